# Optimizing an MI355X kernel written in HIP

```python
import jax
import jax.numpy as jnp
from jax import lax
import numpy as np


D_MODEL = 2048
BATCH = 1
SEQ = 8192
DEPTH = 2

N_BRANCHES = 4
BRANCH_WIDTH = D_MODEL // 4

SB_HEADS = 4
SB_HEAD_DIM = BRANCH_WIDTH // SB_HEADS
SB_BLOCK = 128

GM_GROUPS = 4
GM_GROUP_DIM = BRANCH_WIDTH // GM_GROUPS
GM_CHUNK = 128

GDN_HEADS = 4
GDN_HEAD_DIM = BRANCH_WIDTH // GDN_HEADS
GDN_CONV = 4
GDN_CHUNK = 64

ML_HEADS = 4
ML_QK_DIM = BRANCH_WIDTH // ML_HEADS // 2
ML_V_DIM = BRANCH_WIDTH // ML_HEADS
ML_CHUNK = 64

N_EXPERTS = 64
N_EXPERT_GROUPS = 8
TOPK_GROUPS = 4
TOP_K = 6
EXPERT_DIM = 512
SHARED_DIM = 512
ROUTED_SCALE = 2.5

DEEPNORM_ALPHA = (2 * DEPTH) ** 0.25
DEEPNORM_BETA = (8 * DEPTH) ** -0.25
NORM_EPS = 1e-5

IN_SPLITS = (
    3 * BRANCH_WIDTH,
    2 * BRANCH_WIDTH,
    3 * BRANCH_WIDTH,
    BRANCH_WIDTH,
    GDN_HEADS,
    GDN_HEADS,
    ML_HEADS * ML_QK_DIM,
    ML_HEADS * ML_QK_DIM,
    BRANCH_WIDTH,
    BRANCH_WIDTH,
    ML_HEADS,
    ML_HEADS,
    N_BRANCHES * D_MODEL,
)
IN_COLS = sum(IN_SPLITS)

kernel_name = 'hybrid_sb_gmlp_gdn_mlstm_moe_deepnorm'


def layer_norm(x, g, b):
    x32 = x.astype(jnp.float32)
    mu = jnp.mean(x32, axis=-1, keepdims=True)
    var = jnp.mean(jnp.square(x32 - mu), axis=-1, keepdims=True)
    return ((x32 - mu) * lax.rsqrt(var + NORM_EPS) * g + b).astype(x.dtype)


def rms_norm(x, g):
    x32 = x.astype(jnp.float32)
    return x32 * lax.rsqrt(jnp.mean(jnp.square(x32), axis=-1, keepdims=True) + NORM_EPS) * g


def l2_normalize(x):
    return x * lax.rsqrt(jnp.sum(jnp.square(x), axis=-1, keepdims=True) + 1e-6)


def split_heads(x, h):
    b, t, f = x.shape
    return x.reshape(b, t, h, f // h).transpose(0, 2, 1, 3)


def merge_heads(x):
    b, h, t, d = x.shape
    return x.transpose(0, 2, 1, 3).reshape(b, t, h * d)


def causal_depthwise_conv(x, w):
    k, c = w.shape
    return lax.conv_general_dilated(
        x, w.astype(x.dtype)[:, None, :], window_strides=(1,), padding=[(k - 1, 0)],
        dimension_numbers=('NWC', 'WIO', 'NWC'), feature_group_count=c)


def stick_breaking_attention(q, k, v):
    B_, H, T, d = q.shape
    nb = T // SB_BLOCK
    k32 = k.astype(jnp.float32)
    q_blocks = jnp.moveaxis(q.astype(jnp.float32).reshape(B_, H, nb, SB_BLOCK, d), 2, 0)
    key_pos = jnp.arange(T)

    def block(args):
        q_blk, blk = args
        query_pos = blk * SB_BLOCK + jnp.arange(SB_BLOCK)
        z = jnp.einsum('bhqd,bhkd->bhqk', q_blk, k32) * d ** -0.5
        causal = key_pos[None, :] < query_pos[:, None]
        log_keep = jnp.where(causal, -jax.nn.softplus(z), 0.0)
        log_between = lax.cumsum(log_keep, axis=3, reverse=True) - log_keep
        a = jnp.where(causal, jnp.exp(jax.nn.log_sigmoid(z) + log_between), 0.0)
        return jnp.einsum('bhqk,bhkd->bhqd', a.astype(v.dtype), v)

    out = lax.map(block, (q_blocks, jnp.arange(nb)))
    return jnp.moveaxis(out, 0, 2).reshape(B_, H, T, d)


def chunked_spatial_gating(uv, norm_g, norm_b, w_s, b_s):
    u, v = jnp.split(jax.nn.gelu(uv), 2, axis=-1)
    v = layer_norm(v, norm_g, norm_b)
    B_, T, W = v.shape
    nc = T // GM_CHUNK
    v = v.reshape(B_, nc, GM_CHUNK, GM_GROUPS, GM_GROUP_DIM)
    tri = jnp.tril(jnp.ones((GM_CHUNK, GM_CHUNK), dtype=bool))
    w_causal = jnp.where(tri, w_s, 0.0).astype(v.dtype)
    mixed = jnp.einsum('gts,bnsgc->bntgc', w_causal, v) + b_s.T.astype(v.dtype)[None, None, :, :, None]
    return u * mixed.reshape(B_, T, W)


def chunk_gated_delta_rule(q, k, v, g, beta):
    B_, H, T, dk = q.shape
    dv = v.shape[-1]
    C = GDN_CHUNK
    nc = T // C
    q = q.reshape(B_, H, nc, C, dk)
    k = k.reshape(B_, H, nc, C, dk)
    v = v.reshape(B_, H, nc, C, dv)
    beta = beta.reshape(B_, H, nc, C)
    gc = jnp.cumsum(g.reshape(B_, H, nc, C), axis=-1)
    idx = jnp.arange(C)
    incl = idx[:, None] >= idx[None, :]
    strict = idx[:, None] > idx[None, :]
    decay = jnp.exp(jnp.where(incl, gc[..., :, None] - gc[..., None, :], -jnp.inf))
    kb = k * beta[..., None]
    lmat = jnp.where(strict, jnp.einsum('bhnid,bhnjd->bhnij', kb, k) * decay, 0.0)
    unit_lower = lmat + jnp.eye(C, dtype=lmat.dtype)
    u = lax.linalg.triangular_solve(unit_lower, v * beta[..., None], left_side=True,
                                    lower=True, unit_diagonal=True)
    w = lax.linalg.triangular_solve(unit_lower, kb * jnp.exp(gc)[..., None], left_side=True,
                                    lower=True, unit_diagonal=True)
    attn = jnp.einsum('bhnid,bhnjd->bhnij', q, k) * decay

    def step(s, xs):
        q_c, k_c, u_c, w_c, gc_c, attn_c = xs
        v_new = u_c - jnp.einsum('bhcd,bhde->bhce', w_c, s)
        o = (jnp.einsum('bhcd,bhde->bhce', q_c * jnp.exp(gc_c)[..., None], s)
             + jnp.einsum('bhij,bhje->bhie', attn_c, v_new))
        g_last = gc_c[..., -1:]
        s = (s * jnp.exp(g_last)[..., None]
             + jnp.einsum('bhcd,bhce->bhde', k_c * jnp.exp(g_last - gc_c)[..., None], v_new))
        return s, o

    xs = tuple(jnp.moveaxis(t, 2, 0) for t in (q, k, u, w, gc, attn))
    s0 = jnp.zeros((B_, H, dk, dv), jnp.float32)
    _, o = lax.scan(step, s0, xs)
    return jnp.moveaxis(o, 0, 2).reshape(B_, H, T, dv)


def mlstm_chunkwise(q, k, v, i_pre, f_pre):
    B_, H, T, dqk = q.shape
    dv = v.shape[-1]
    C = ML_CHUNK
    nc = T // C
    q = (q * dqk ** -0.5).reshape(B_, H, nc, C, dqk)
    k = k.reshape(B_, H, nc, C, dqk)
    v = v.reshape(B_, H, nc, C, dv)
    i_pre = i_pre.reshape(B_, H, nc, C)
    b = jnp.cumsum(jax.nn.log_sigmoid(f_pre).reshape(B_, H, nc, C), axis=-1)
    idx = jnp.arange(C)
    incl = idx[:, None] >= idx[None, :]

    def step(carry, xs):
        c_mat, n_vec, m = carry
        q_c, k_c, v_c, i_c, b_c = xs
        log_intra = jnp.where(incl, b_c[..., :, None] - b_c[..., None, :] + i_c[..., None, :], -jnp.inf)
        log_inter = b_c + m[..., None]
        m_out = jnp.maximum(log_inter, jnp.max(log_intra, axis=-1))
        w_inter = jnp.exp(log_inter - m_out)
        s = jnp.exp(log_intra - m_out[..., None]) * jnp.einsum('bhid,bhjd->bhij', q_c, k_c)
        num = (w_inter[..., None] * jnp.einsum('bhcd,bhde->bhce', q_c, c_mat)
               + jnp.einsum('bhij,bhje->bhie', s, v_c))
        den = w_inter * jnp.einsum('bhcd,bhd->bhc', q_c, n_vec) + jnp.sum(s, axis=-1)
        h = num / jnp.maximum(jnp.abs(den), jnp.exp(-m_out))[..., None]
        b_last = b_c[..., -1]
        log_kv = b_last[..., None] - b_c + i_c
        m_new = jnp.maximum(b_last + m, jnp.max(log_kv, axis=-1))
        w_kv = jnp.exp(log_kv - m_new[..., None])
        carry_decay = jnp.exp(b_last + m - m_new)
        c_mat = carry_decay[..., None, None] * c_mat + jnp.einsum('bhc,bhcd,bhce->bhde', w_kv, k_c, v_c)
        n_vec = carry_decay[..., None] * n_vec + jnp.einsum('bhc,bhcd->bhd', w_kv, k_c)
        return (c_mat, n_vec, m_new), h

    init = (jnp.zeros((B_, H, dqk, dv), jnp.float32),
            jnp.zeros((B_, H, dqk), jnp.float32),
            jnp.zeros((B_, H), jnp.float32))
    xs = tuple(jnp.moveaxis(t, 2, 0) for t in (q, k, v, i_pre, b))
    _, h = lax.scan(step, init, xs)
    return jnp.moveaxis(h, 0, 2).reshape(B_, H, T, dv)


def hybrid_mixer(x, w_in, gm_norm_g, gm_norm_b, gm_w_s, gm_b_s, gdn_conv_w, gdn_a_log,
                 gdn_dt_bias, gdn_norm_g, ml_i_bias, ml_f_bias, ml_norm_g, w_branch, w_out):
    B_, T, D = x.shape
    f32 = jnp.float32
    z = jnp.einsum('btd,dc->btc', x, w_in)
    split_points = [int(c) for c in np.cumsum(IN_SPLITS)[:-1]]
    (sb_qkv, gm_uv, gdn_qkv, gdn_gate, gdn_b, gdn_a,
     ml_q, ml_k, ml_v, ml_o, ml_i, ml_f, gate_logits) = jnp.split(z, split_points, axis=-1)

    sq, sk, sv = (split_heads(t, SB_HEADS) for t in jnp.split(sb_qkv, 3, axis=-1))
    out_a = merge_heads(stick_breaking_attention(sq, sk, sv))

    out_b = chunked_spatial_gating(gm_uv, gm_norm_g, gm_norm_b, gm_w_s, gm_b_s)

    qkv = jax.nn.silu(causal_depthwise_conv(gdn_qkv, gdn_conv_w))
    gq, gk, gv = jnp.split(qkv, 3, axis=-1)
    gq = l2_normalize(split_heads(gq, GDN_HEADS).astype(f32)) * GDN_HEAD_DIM ** -0.5
    gk = l2_normalize(split_heads(gk, GDN_HEADS).astype(f32))
    gv = split_heads(gv, GDN_HEADS).astype(f32)
    beta = jax.nn.sigmoid(gdn_b.astype(f32)).transpose(0, 2, 1)
    g = (-jnp.exp(gdn_a_log.astype(f32))
         * jax.nn.softplus(gdn_a.astype(f32) + gdn_dt_bias.astype(f32))).transpose(0, 2, 1)
    o = rms_norm(chunk_gated_delta_rule(gq, gk, gv, g, beta), gdn_norm_g)
    out_c = merge_heads(o).astype(x.dtype) * jax.nn.silu(gdn_gate)

    h = mlstm_chunkwise(split_heads(ml_q, ML_HEADS).astype(f32),
                        split_heads(ml_k, ML_HEADS).astype(f32),
                        split_heads(ml_v, ML_HEADS).astype(f32),
                        (ml_i.astype(f32) + ml_i_bias.astype(f32)).transpose(0, 2, 1),
                        (ml_f.astype(f32) + ml_f_bias.astype(f32)).transpose(0, 2, 1))
    h = rms_norm(h, ml_norm_g.reshape(ML_HEADS, 1, ML_V_DIM))
    out_d = merge_heads(h).astype(x.dtype) * jax.nn.sigmoid(ml_o)

    branches = jnp.stack([out_a, out_b, out_c, out_d], axis=2)
    proj = jnp.einsum('btgc,gcd->btgd', branches, w_branch)
    gates = jax.nn.sigmoid(gate_logits.reshape(B_, T, N_BRANCHES, D))
    return jnp.einsum('btd,de->bte', jnp.sum(gates * proj, axis=2), w_out)


def moe_ffn(x, w_router, router_bias, w_gate, w_up, w_down, ws_gate, ws_up, ws_down):
    B_, T, D = x.shape
    xt = x.reshape(B_ * T, D)
    n = xt.shape[0]
    scores = jax.nn.sigmoid(jnp.einsum('nd,de->ne', xt.astype(jnp.float32), w_router.astype(jnp.float32)))
    biased = scores + router_bias.astype(jnp.float32)
    per_group = N_EXPERTS // N_EXPERT_GROUPS
    group_score = jnp.sum(lax.top_k(biased.reshape(n, N_EXPERT_GROUPS, per_group), 2)[0], axis=-1)
    _, top_groups = lax.top_k(group_score, TOPK_GROUPS)
    group_mask = jnp.sum(jax.nn.one_hot(top_groups, N_EXPERT_GROUPS, dtype=jnp.float32), axis=1)
    expert_mask = jnp.repeat(group_mask, per_group, axis=-1) > 0
    _, top_idx = lax.top_k(jnp.where(expert_mask, biased, -jnp.inf), TOP_K)
    sel = jnp.take_along_axis(scores, top_idx, axis=-1)
    weights = sel / jnp.sum(sel, axis=-1, keepdims=True) * ROUTED_SCALE
    combine = jnp.einsum('nk,nke->ne', weights, jax.nn.one_hot(top_idx, N_EXPERTS, dtype=jnp.float32))

    shared = (jax.nn.silu(xt @ ws_gate) * (xt @ ws_up)) @ ws_down

    def expert(acc, p):
        wg, wu, wd, c = p
        hidden = jax.nn.silu(xt @ wg) * (xt @ wu)
        return acc + (hidden @ wd) * c.astype(acc.dtype)[:, None], None

    out, _ = lax.scan(expert, shared, (w_gate, w_up, w_down, combine.T))
    return out.reshape(B_, T, D)


def setup_inputs(seed: int = 0) -> dict:
    key = jax.random.key(seed)
    ks = jax.random.split(key, 32)
    f32 = jnp.float32
    L, D, W = DEPTH, D_MODEL, BRANCH_WIDTH

    def nrm(k, shape, scale):
        return jax.random.normal(k, shape, f32) * scale

    dt = jnp.exp(jax.random.uniform(ks[8], (L, GDN_HEADS), f32, float(np.log(1e-3)), float(np.log(1e-1))))
    return {
        'x': nrm(ks[0], (BATCH, SEQ, D), 1.0),
        'w_in': nrm(ks[1], (L, D, IN_COLS), D ** -0.5),
        'gm_norm_g': 1.0 + nrm(ks[2], (L, W), 0.02),
        'gm_norm_b': nrm(ks[3], (L, W), 0.02),
        'gm_w_s': nrm(ks[4], (L, GM_GROUPS, GM_CHUNK, GM_CHUNK), GM_CHUNK ** -0.5),
        'gm_b_s': 1.0 + nrm(ks[5], (L, GM_GROUPS, GM_CHUNK), 0.02),
        'gdn_conv_w': nrm(ks[6], (L, GDN_CONV, 3 * W), GDN_CONV ** -0.5),
        'gdn_a_log': jnp.log(jax.random.uniform(ks[7], (L, GDN_HEADS), f32, 1.0, 16.0)),
        'gdn_dt_bias': dt + jnp.log(-jnp.expm1(-dt)),
        'gdn_norm_g': 1.0 + nrm(ks[9], (L, GDN_HEAD_DIM), 0.02),
        'ml_i_bias': nrm(ks[10], (L, ML_HEADS), 0.1),
        'ml_f_bias': 3.0 + nrm(ks[11], (L, ML_HEADS), 0.5),
        'ml_norm_g': 1.0 + nrm(ks[12], (L, W), 0.02),
        'w_branch': nrm(ks[13], (L, N_BRANCHES, W, D), W ** -0.5 * DEEPNORM_BETA),
        'w_out': nrm(ks[14], (L, D, D), D ** -0.5 * DEEPNORM_BETA),
        'ln1_g': 1.0 + nrm(ks[15], (L, D), 0.02),
        'ln1_b': nrm(ks[16], (L, D), 0.02),
        'w_router': nrm(ks[17], (L, D, N_EXPERTS), D ** -0.5),
        'router_bias': nrm(ks[18], (L, N_EXPERTS), 0.01),
        'w_gate': nrm(ks[19], (L, N_EXPERTS, D, EXPERT_DIM), D ** -0.5),
        'w_up': nrm(ks[20], (L, N_EXPERTS, D, EXPERT_DIM), D ** -0.5),
        'w_down': nrm(ks[21], (L, N_EXPERTS, EXPERT_DIM, D), EXPERT_DIM ** -0.5 * DEEPNORM_BETA),
        'ws_gate': nrm(ks[22], (L, D, SHARED_DIM), D ** -0.5),
        'ws_up': nrm(ks[23], (L, D, SHARED_DIM), D ** -0.5),
        'ws_down': nrm(ks[24], (L, SHARED_DIM, D), SHARED_DIM ** -0.5 * DEEPNORM_BETA),
        'ln2_g': 1.0 + nrm(ks[25], (L, D), 0.02),
        'ln2_b': nrm(ks[26], (L, D), 0.02),
    }


def reference(x, w_in, gm_norm_g, gm_norm_b, gm_w_s, gm_b_s, gdn_conv_w, gdn_a_log,
              gdn_dt_bias, gdn_norm_g, ml_i_bias, ml_f_bias, ml_norm_g, w_branch, w_out,
              ln1_g, ln1_b, w_router, router_bias, w_gate, w_up, w_down,
              ws_gate, ws_up, ws_down, ln2_g, ln2_b):
    for l in range(DEPTH):
        mix = hybrid_mixer(x, w_in[l], gm_norm_g[l], gm_norm_b[l], gm_w_s[l], gm_b_s[l],
                           gdn_conv_w[l], gdn_a_log[l], gdn_dt_bias[l], gdn_norm_g[l],
                           ml_i_bias[l], ml_f_bias[l], ml_norm_g[l], w_branch[l], w_out[l])
        x = layer_norm(DEEPNORM_ALPHA * x + mix, ln1_g[l], ln1_b[l])
        ffn = moe_ffn(x, w_router[l], router_bias[l], w_gate[l], w_up[l], w_down[l],
                      ws_gate[l], ws_up[l], ws_down[l])
        x = layer_norm(DEEPNORM_ALPHA * x + ffn, ln2_g[l], ln2_b[l])
    return x
```

```cpp
#include <hip/hip_runtime.h>
#include <cstdio>
#include <cstdint>
namespace pg8 {
#define PG8_LAS __attribute__((address_space(3)))
typedef unsigned short bf16_t;
typedef short bf16x8 __attribute__((ext_vector_type(8)));
typedef float f32x4 __attribute__((ext_vector_type(4)));
typedef unsigned u32x4 __attribute__((ext_vector_type(4)));
constexpr int BM = 256, BK = 64, HALF = 128, HTB = HALF * BK * 2  , STAGE_BYTES = 8 * HTB, NXCD = 8, WGM = 8;

__host__ __device__ __forceinline__ int lds_byte(int r, int c) { const int st = (r >> 4) * 2 + (c >> 5), rr = r & 15, cc = c & 31, ob = rr * 64 + cc * 2; return st * 1024 + (ob ^ (((ob >> 9) & 1) << 5)); }
__host__ __device__ __forceinline__ void stage_rc(int b, int& R, int& C) { const int st = b / 1024, sb = b % 1024, swz = sb ^ (((sb >> 9) & 1) << 5); R = (st >> 1) * 16 + swz / 64; C = (st & 1) * 32 + (swz % 64) / 2; }
__host__ __device__ __forceinline__ int perm32(int rho) { const int n = rho >> 4, i = rho & 15; return 8 * (i >> 2) + 4 * n + (i & 3); }

struct Unit { int pm, pn; };
struct Gemm { const bf16_t* A; const bf16_t* Bt; int M, N, K, lda, ldb; };

struct StaticOrder {
    int nM, nN, nwg, G, c;
    __host__ __device__ void init(int M, int N, int G_, int c_) { nM = M / BM; nN = N / BM; nwg = nM * nN; G = G_; c = c_; }
    __host__ __device__ bool next(int i, Unit& u) const {
        const long L = (long)i * G + c; if (L >= nwg) return false;
        int wgid = (int)L; { const int q = nwg / NXCD, r = nwg % NXCD, xcd = wgid % NXCD, off = wgid / NXCD; wgid = (xcd < r ? xcd * (q + 1) : r * (q + 1) + (xcd - r) * q) + off; }
        const int nig = WGM * nN, gid = wgid / nig, fm = gid * WGM, gsz = (nM - fm) < WGM ? (nM - fm) : WGM;
        u.pm = fm + ((wgid % nig) % gsz); u.pn = (wgid % nig) / gsz; return true;
    }
    __device__ __forceinline__ void a_ready(const Unit&) const {}
    __device__ __forceinline__ void done(const Unit&) const {}
};

__device__ __forceinline__ unsigned cvt_pk_bf16(float lo, float hi) { unsigned r; asm volatile("v_cvt_pk_bf16_f32 %0, %1, %2" : "=v"(r) : "v"(lo), "v"(hi)); return r; }
typedef float f32x2 __attribute__((ext_vector_type(2)));
__device__ __forceinline__ f32x2 gelu_pk(f32x2 v) {
    const f32x2 av = __builtin_elementwise_abs(v), d = av * 0.2316418882f + 1.0f;
    f32x2 t; t.x = __builtin_amdgcn_rcpf(d.x); t.y = __builtin_amdgcn_rcpf(d.y);
    f32x2 q = t * 0.5307027145f + (-0.7265760135f); q = q * t + 0.7107068705f; q = q * t + (-0.142248368f); q = q * t + 0.127414796f; q = q * t;
    const f32x2 s = (v * v) * (-0.72134752044f);
    f32x2 e; e.x = __builtin_amdgcn_exp2f(s.x); e.y = __builtin_amdgcn_exp2f(s.y);
    const f32x2 m = v * (q * e), r = v - m;
    f32x2 o; o.x = v.x < 0.f ? m.x : r.x; o.y = v.y < 0.f ? m.y : r.y; return o;
}

template <int ACT  > struct EpiBf16 {
    static constexpr bool PERM = true, AFTER_DRAIN = false; static_assert(ACT == 0 || ACT == 1, "EpiBf16: ACT is 0 (none) or 1 (gelu_pk)");
    bf16_t* O; int ldc; const float* bias; int split_cols; size_t split_stride; float scale0;
    __device__ __forceinline__ void operator()(const f32x4 (&acc)[2][2][4][2], const Unit& u, int wr, int wc, int fr, int fq) const {
        const int row0 = u.pm * BM + wr * 64 + fr; int colt = u.pn * BM; bf16_t* base = O;
        float sc = 1.f; if (split_cols) { const int t = colt / split_cols; base += (size_t)t * split_stride; colt -= t * split_cols; if (t == 0) sc = scale0; }
        const int col0 = colt + wc * 32 + 8 * fq, bcol0 = u.pn * BM + wc * 32 + 8 * fq;
        f32x4 bv[2][2];
#pragma unroll
        for (int bj = 0; bj < 2; ++bj)
#pragma unroll
            for (int n = 0; n < 2; ++n) bv[bj][n] = bias ? *(const f32x4*)(bias + bcol0 + bj * HALF + 4 * n) : (f32x4){0.f, 0.f, 0.f, 0.f};
#pragma unroll
        for (int ai = 0; ai < 2; ++ai)
#pragma unroll
            for (int m = 0; m < 4; ++m) { bf16_t* rowp = base + (size_t)(row0 + ai * HALF + m * 16) * ldc + col0;
#pragma unroll
                for (int bj = 0; bj < 2; ++bj) { f32x4 v0 = acc[ai][bj][m][0] + bv[bj][0], v1 = acc[ai][bj][m][1] + bv[bj][1];
                    if (ACT == 1) { f32x2 a = gelu_pk((f32x2){v0[0], v0[1]}), b = gelu_pk((f32x2){v0[2], v0[3]}), c = gelu_pk((f32x2){v1[0], v1[1]}), d = gelu_pk((f32x2){v1[2], v1[3]});
                        v0 = (f32x4){a.x, a.y, b.x, b.y}; v1 = (f32x4){c.x, c.y, d.x, d.y}; }
                    v0 = v0 * sc; v1 = v1 * sc; u32x4 w; w.x = cvt_pk_bf16(v0[0], v0[1]); w.y = cvt_pk_bf16(v0[2], v0[3]); w.z = cvt_pk_bf16(v1[0], v1[1]); w.w = cvt_pk_bf16(v1[2], v1[3]);
                    *(u32x4*)(rowp + bj * HALF) = w; } }
    }
};

template <class Epi, class Sched, bool ALIGN_EPI = false, bool SP2 = false>
__device__ __forceinline__ void gemm_phase(PG8_LAS unsigned char* lds, const Gemm g, const Sched& S, const Epi& E) {
    const int tid = threadIdx.x, wid = __builtin_amdgcn_readfirstlane(tid >> 6), lane = tid & 63, wr = wid >> 2, wc = wid & 3, fr = lane & 15, fq = lane >> 4;
    const int K = g.K, nt = K / BK;
    unsigned voffA[2], voffB[2];
#pragma unroll
    for (int i = 0; i < 2; ++i) { int R, C; stage_rc(tid * 16 + i * 8192, R, C); const int Rb = Epi::PERM ? ((R & ~31) + perm32(R & 31)) : R;
        voffA[i] = (unsigned)(R * g.lda + C) * 2u; voffB[i] = (unsigned)(Rb * g.ldb + C) * 2u; }
    const size_t kstep = (size_t)(BK * 2);
    const size_t hstepA = (size_t)HALF * g.lda * 2, hstepB = (size_t)HALF * g.ldb * 2;
    const size_t tstepA = 2 * hstepA, tstepB = 2 * hstepB;
    const unsigned ldsw = (unsigned)wid * 1024u;
    const int aoff = lds_byte(wr * 64 + fr, fq * 8), boff = lds_byte(wc * 32 + fr, fq * 8);
#define PG8_SA(b, h) (((b) * 2 + (h)) * HTB)
#define PG8_SB(b, h) ((4 + (b) * 2 + (h)) * HTB)
#define PG8_STAGE(bufoff, gbase, voff) do { _Pragma("unroll") for (int _i = 0; _i < 2; ++_i) \
        __builtin_amdgcn_global_load_lds((const unsigned*)((const char*)(gbase) + (voff)[_i]), (PG8_LAS unsigned*)(lds + (bufoff) + ldsw + _i * 8192), 16, 0, 0); } while (0)
#define PG8_LDA(dst, b, h) do { _Pragma("unroll") for (int m = 0; m < 4; ++m) _Pragma("unroll") for (int k = 0; k < 2; ++k) dst[m][k] = *(const PG8_LAS bf16x8*)(lds + PG8_SA(b, h) + aoff + m * 2048 + k * 1024); } while (0)
#define PG8_LDB(dst, b, h) do { _Pragma("unroll") for (int n = 0; n < 2; ++n) _Pragma("unroll") for (int k = 0; k < 2; ++k) dst[n][k] = *(const PG8_LAS bf16x8*)(lds + PG8_SB(b, h) + boff + n * 2048 + k * 1024); } while (0)
#define PG8_MMA(ai, bj, At, Bt) do { __builtin_amdgcn_s_setprio(1); _Pragma("unroll") for (int m = 0; m < 4; ++m) _Pragma("unroll") for (int n = 0; n < 2; ++n) _Pragma("unroll") for (int k = 0; k < 2; ++k) \
        acc[ai][bj][m][n] = __builtin_amdgcn_mfma_f32_16x16x32_bf16(Bt[n][k], At[m][k], acc[ai][bj][m][n], 0, 0, 0); __builtin_amdgcn_s_setprio(0); } while (0)
#define PG8_WAIT_V(n) asm volatile("s_waitcnt vmcnt(" #n ")" ::: "memory")
#define PG8_WAIT_L(n) asm volatile("s_waitcnt lgkmcnt(" #n ")" ::: "memory")
#define PG8_BAR __builtin_amdgcn_s_barrier()
#define PG8_SCHED __builtin_amdgcn_sched_barrier(0)
    Unit cur, nxt; int ui = 0;
    if (!S.next(0, cur)) return;
    f32x4 acc[2][2][4][2];
#pragma unroll
    for (int a = 0; a < 2; ++a)
#pragma unroll
        for (int b = 0; b < 2; ++b)
#pragma unroll
            for (int m = 0; m < 4; ++m)
#pragma unroll
                for (int n = 0; n < 2; ++n) acc[a][b][m][n] = (f32x4){0.f, 0.f, 0.f, 0.f};
    bf16x8 At[4][2], B0[2][2], B1[2][2];
    const char* cA = (const char*)g.A + (size_t)cur.pm * tstepA; const char* cB = (const char*)g.Bt + (size_t)cur.pn * tstepB;
    S.a_ready(cur);
    if constexpr (SP2) {
        PG8_STAGE(PG8_SB(0, 0), cB, voffB); PG8_STAGE(PG8_SB(0, 1), cB + hstepB, voffB); PG8_STAGE(PG8_SA(0, 0), cA, voffA); PG8_STAGE(PG8_SA(0, 1), cA + hstepA, voffA);
        if (wr == 1) PG8_BAR;
        PG8_WAIT_V(2); PG8_BAR;
        PG8_STAGE(PG8_SB(1, 0), cB + kstep, voffB); PG8_STAGE(PG8_SA(1, 0), cA + kstep, voffA); PG8_STAGE(PG8_SB(1, 1), cB + hstepB + kstep, voffB);
        PG8_WAIT_V(6); PG8_BAR;
    } else {
        PG8_STAGE(PG8_SB(0, 0), cB, voffB); PG8_STAGE(PG8_SA(0, 0), cA, voffA); PG8_STAGE(PG8_SB(0, 1), cB + hstepB, voffB); PG8_STAGE(PG8_SA(0, 1), cA + hstepA, voffA);
        if (wr == 1) PG8_BAR;
        PG8_WAIT_V(4); PG8_BAR;
        PG8_STAGE(PG8_SB(1, 0), cB + kstep, voffB); PG8_STAGE(PG8_SA(1, 0), cA + kstep, voffA); PG8_STAGE(PG8_SB(1, 1), cB + hstepB + kstep, voffB);
        PG8_WAIT_V(6); PG8_BAR;
    }
    for (;;) {
        const bool has_next = S.next(ui + 1, nxt);
        const char* nA = has_next ? (const char*)g.A + (size_t)nxt.pm * tstepA : cA; const char* nB = has_next ? (const char*)g.Bt + (size_t)nxt.pn * tstepB : cB;
        for (int t = 0; t < nt; t += 2) {
            const bool last = (t == nt - 2);
            const char* a1 = cA + (size_t)(t + 1) * kstep;
            const char* a2 = last ? nA : cA + (size_t)(t + 2) * kstep; const char* b2 = last ? nB : cB + (size_t)(t + 2) * kstep;
            const char* a3 = a2 + kstep; const char* b3 = b2 + kstep;
            if (last && has_next) S.a_ready(nxt);
            if constexpr (SP2) {
            PG8_LDB(B0, 0, 0); PG8_LDB(B1, 0, 1); PG8_SCHED; PG8_LDA(At, 0, 0); PG8_STAGE(PG8_SA(1, 1), a1 + hstepA, voffA);
            PG8_WAIT_V(8); PG8_WAIT_L(0); PG8_BAR; PG8_MMA(0, 0, At, B0); PG8_MMA(0, 1, At, B1); PG8_BAR; PG8_SCHED;
            PG8_LDA(At, 0, 1); PG8_STAGE(PG8_SB(0, 0), b2, voffB); PG8_STAGE(PG8_SB(0, 1), b2 + hstepB, voffB); PG8_STAGE(PG8_SA(0, 0), a2, voffA);
            PG8_WAIT_V(8); PG8_WAIT_L(0); PG8_BAR; PG8_MMA(1, 0, At, B0); PG8_MMA(1, 1, At, B1); PG8_BAR; PG8_SCHED;
            PG8_LDB(B0, 1, 0); PG8_LDB(B1, 1, 1); PG8_SCHED; PG8_LDA(At, 1, 0); PG8_STAGE(PG8_SA(0, 1), a2 + hstepA, voffA);
            PG8_WAIT_V(8); PG8_WAIT_L(0); PG8_BAR; PG8_MMA(0, 0, At, B0); PG8_MMA(0, 1, At, B1); PG8_BAR; PG8_SCHED;
            PG8_LDA(At, 1, 1); PG8_STAGE(PG8_SB(1, 0), b3, voffB); PG8_STAGE(PG8_SB(1, 1), b3 + hstepB, voffB); PG8_STAGE(PG8_SA(1, 0), a3, voffA);
            PG8_WAIT_V(8); PG8_WAIT_L(0); PG8_BAR; PG8_MMA(1, 0, At, B0); PG8_MMA(1, 1, At, B1); PG8_BAR; PG8_SCHED;
            } else {
            PG8_LDB(B0, 0, 0); PG8_SCHED; PG8_LDA(At, 0, 0); PG8_STAGE(PG8_SA(1, 1), a1 + hstepA, voffA);
            PG8_WAIT_L(8); PG8_BAR; PG8_WAIT_L(0); PG8_MMA(0, 0, At, B0); PG8_BAR; PG8_SCHED;
            PG8_LDB(B1, 0, 1); PG8_STAGE(PG8_SB(0, 0), b2, voffB);
            PG8_BAR; PG8_WAIT_L(0); PG8_MMA(0, 1, At, B1); PG8_BAR;
            PG8_LDA(At, 0, 1); PG8_STAGE(PG8_SA(0, 0), a2, voffA);
            PG8_BAR; PG8_WAIT_L(0); PG8_MMA(1, 0, At, B0); PG8_BAR; PG8_SCHED;
            PG8_STAGE(PG8_SB(0, 1), b2 + hstepB, voffB);
            PG8_WAIT_V(6); PG8_BAR; PG8_MMA(1, 1, At, B1); PG8_BAR;
            PG8_LDB(B0, 1, 0); PG8_SCHED; PG8_LDA(At, 1, 0); PG8_STAGE(PG8_SA(0, 1), a2 + hstepA, voffA);
            PG8_WAIT_L(8); PG8_BAR; PG8_WAIT_L(0); PG8_MMA(0, 0, At, B0); PG8_BAR; PG8_SCHED;
            PG8_LDB(B1, 1, 1); PG8_STAGE(PG8_SB(1, 0), b3, voffB);
            PG8_BAR; PG8_WAIT_L(0); PG8_MMA(0, 1, At, B1); PG8_BAR;
            PG8_LDA(At, 1, 1); PG8_STAGE(PG8_SA(1, 0), a3, voffA);
            PG8_BAR; PG8_WAIT_L(0); PG8_MMA(1, 0, At, B0); PG8_BAR; PG8_SCHED;
            PG8_STAGE(PG8_SB(1, 1), b3 + hstepB, voffB);
            PG8_WAIT_V(6); PG8_BAR; PG8_MMA(1, 1, At, B1); PG8_BAR;
            }
        }
        if constexpr (ALIGN_EPI) { if (wr == 0) PG8_BAR; }
        if constexpr (!Epi::AFTER_DRAIN) { E(acc, cur, wr, wc, fr, fq); S.done(cur); }
        if (!has_next) break;
#pragma unroll
        for (int a = 0; a < 2; ++a)
#pragma unroll
            for (int b = 0; b < 2; ++b)
#pragma unroll
                for (int m = 0; m < 4; ++m)
#pragma unroll
                    for (int n = 0; n < 2; ++n) acc[a][b][m][n] = (f32x4){0.f, 0.f, 0.f, 0.f};
        cur = nxt; cA = nA; cB = nB; ++ui;
        if constexpr (ALIGN_EPI) { if (wr == 1) PG8_BAR; }
    }
    PG8_WAIT_V(0);
    if constexpr (!ALIGN_EPI) { if (wr == 0) PG8_BAR; }
    PG8_BAR;
    if constexpr (Epi::AFTER_DRAIN) { E.fused(acc, cur, wr, wc, fr, fq, lds, wid, lane); S.done(cur); }
#undef PG8_SA
#undef PG8_SB
#undef PG8_STAGE
#undef PG8_LDA
#undef PG8_LDB
#undef PG8_MMA
#undef PG8_WAIT_V
#undef PG8_WAIT_L
#undef PG8_BAR
#undef PG8_SCHED
}
}

constexpr int T = 8192, D = 2048, NL = 2, BW = 512, ZC = 14336, INC = 14352;
constexpr int NE = 64, NEX = 65  , ED = 512;
constexpr int HK = NEX * ED;
constexpr float ALPHA = 1.41421356237f;
constexpr float LN_EPS = 1e-5f;
constexpr int ZC_SBQ = 0, ZC_SBK = 512, ZC_SBV = 1024, ZC_GMU = 1536, ZC_GMV = 2048, ZC_GDN = 2560, ZC_GDNG = 4096,
              ZC_MLQ = 4608, ZC_MLK = 4864, ZC_MLV = 5120, ZC_MLO = 5632, ZC_GATE = 6144;

#define GAS __attribute__((address_space(1)))
#define LAS __attribute__((address_space(3)))
typedef unsigned short bf16;
typedef unsigned v4u __attribute__((ext_vector_type(4)));
typedef unsigned v2u __attribute__((ext_vector_type(2)));
typedef float v4f __attribute__((ext_vector_type(4)));
typedef float v2f __attribute__((ext_vector_type(2)));
#define LDS_WAIT() asm volatile("s_waitcnt lgkmcnt(0)" ::: "memory")

constexpr size_t MiB = 1u << 20;
constexpr size_t WS_CTL = 0, CTL_ZERO_BYTES = 1 * MiB;
constexpr size_t WS_WIN = 2 * MiB, WS_WBR = 58 * MiB, WS_WOUT = 66 * MiB, WS_WUP = 74 * MiB, WS_WDN = 334 * MiB;
constexpr size_t WS_XB = 464 * MiB, WS_SMALL = 496 * MiB, WS_EG = 497 * MiB, WS_BETA = WS_EG + 256 * 1024, WS_COMB = 498 * MiB;
constexpr size_t WS_Z = 500 * MiB, WS_GQ = 724 * MiB, WS_GK = 740 * MiB, WS_GV = 756 * MiB, WS_GO = 772 * MiB, WS_HO = 788 * MiB;
constexpr size_t WS_BR = 804 * MiB, WS_MTMP = 836 * MiB, WS_MSUM = 900 * MiB, WS_Y = 932 * MiB, WS_X1 = 996 * MiB, WS_X1B = 1060 * MiB;
constexpr size_t WS_XCUR = 1092 * MiB, WS_HB = 1156 * MiB, WS_END = 1676 * MiB;
static_assert(WS_WIN + (size_t)ZC * D * 2 <= WS_WBR && WS_WUP + (size_t)NEX * 1024 * D * 2 <= WS_WDN && WS_WDN + (size_t)D * HK * 2 <= WS_XB, "ws map (weights)");
static_assert(WS_Z + (size_t)T * ZC * 2 <= WS_GQ && WS_HB + (size_t)T * HK * 2 <= WS_END, "ws map (acts)");
constexpr int CW_BAR = 4096;
constexpr int LDS_BYTES = 147456, MISC_OFF = 131072 + 320;

__device__ __forceinline__ float bflo(unsigned w) { return __uint_as_float(w << 16); }
__device__ __forceinline__ float bfhi(unsigned w) { return __uint_as_float(w & 0xffff0000u); }
__device__ __forceinline__ unsigned f2bf(float f) { unsigned u = __float_as_uint(f); return (u + 0x7fffu + ((u >> 16) & 1u)) >> 16; }
__device__ __forceinline__ unsigned pk2(float lo, float hi) { return f2bf(lo) | (f2bf(hi) << 16); }
template <int CTRL> __device__ __forceinline__ float dpp(float x) { return __builtin_bit_cast(float, __builtin_amdgcn_mov_dpp(__builtin_bit_cast(int, x), CTRL, 0xf, 0xf, true)); }
__device__ __forceinline__ float sum4(float x) { x += dpp<0xB1>(x); x += dpp<0x4E>(x); return x; }
__device__ __forceinline__ float sum8(float x) { x = sum4(x); x += dpp<0x141>(x); return x; }
__device__ __forceinline__ float sum16(float x) { x = sum8(x); x += dpp<0x140>(x); return x; }
__device__ __forceinline__ float wave_sum(float x) { x = sum16(x); x += __shfl_xor(x, 16); x += __shfl_xor(x, 32); return x; }
__device__ __forceinline__ float max8(float x) { x = fmaxf(x, dpp<0xB1>(x)); x = fmaxf(x, dpp<0x4E>(x)); x = fmaxf(x, dpp<0x141>(x)); return x; }
__device__ __forceinline__ float min8(float x) { x = fminf(x, dpp<0xB1>(x)); x = fminf(x, dpp<0x4E>(x)); x = fminf(x, dpp<0x141>(x)); return x; }
__device__ __forceinline__ float wave_scan_incl(float v) {
    v += __builtin_bit_cast(float, __builtin_amdgcn_update_dpp(0, __builtin_bit_cast(int, v), 0x111, 0xf, 0xf, true));
    v += __builtin_bit_cast(float, __builtin_amdgcn_update_dpp(0, __builtin_bit_cast(int, v), 0x112, 0xf, 0xf, true));
    v += __builtin_bit_cast(float, __builtin_amdgcn_update_dpp(0, __builtin_bit_cast(int, v), 0x114, 0xf, 0xf, true));
    v += __builtin_bit_cast(float, __builtin_amdgcn_update_dpp(0, __builtin_bit_cast(int, v), 0x118, 0xf, 0xf, true));
    v += __builtin_bit_cast(float, __builtin_amdgcn_update_dpp(0, __builtin_bit_cast(int, v), 0x142, 0xa, 0xf, false));
    v += __builtin_bit_cast(float, __builtin_amdgcn_update_dpp(0, __builtin_bit_cast(int, v), 0x143, 0xc, 0xf, false));
    return v;
}
__device__ __forceinline__ float sigmoidf_(float x) { return 1.f / (1.f + __expf(-x)); }
__device__ __forceinline__ float siluf_(float x) { return x / (1.f + __expf(-x)); }
__device__ __forceinline__ float softplusf_(float x) { return fmaxf(x, 0.f) + __logf(1.f + __expf(-fabsf(x))); }
__device__ __forceinline__ float gelu_tanh(float x) { const float y = 0.7978845608f * (x + 0.044715f * x * x * x); const float t = 1.f - 2.f / (__expf(2.f * y) + 1.f); return 0.5f * x * (1.f + t); }
__device__ __forceinline__ void unpack8(const v4u r, float (&f)[8]) { f[0] = bflo(r.x); f[1] = bfhi(r.x); f[2] = bflo(r.y); f[3] = bfhi(r.y); f[4] = bflo(r.z); f[5] = bfhi(r.z); f[6] = bflo(r.w); f[7] = bfhi(r.w); }
#define XB_TMO      128
#define XB_XCNT(j)  (256  + 64 * (j))
#define XB_XSUB(j)  (1280 + 64 * (j))
#define XB_XGEN(j)  (2304 + 64 * (j))
#define XB_TOP      3328
#define XB_TOPGEN   3392
#define XCD_BAR_WORDS 3456
#define XB_SPIN_CAP (1u << 18)

__device__ __forceinline__ unsigned xb_ld(unsigned* p)              { return __hip_atomic_load(p, __ATOMIC_RELAXED, __HIP_MEMORY_SCOPE_AGENT); }
__device__ __forceinline__ unsigned xb_add(unsigned* p, unsigned v) { return __hip_atomic_fetch_add(p, v, __ATOMIC_RELAXED, __HIP_MEMORY_SCOPE_AGENT); }
__device__ __forceinline__ unsigned xb_xcc_id() { return (unsigned)__builtin_amdgcn_s_getreg((3 << 11) | 20) & 0xFu; }
#define XB_SPIN(cond, bar) do { unsigned _sp = 0; while (cond) { __builtin_amdgcn_s_sleep(1); \
    if ((++_sp & 255u) == 0u) { if (xb_ld(&(bar)[XB_TMO])) break; if (_sp > XB_SPIN_CAP) { atomicAdd(&(bar)[XB_TMO], 1u); break; } } } } while (0)

struct XcdBarrier {
    unsigned* bar; unsigned x;
    volatile LAS unsigned* st;
};

__device__ __forceinline__ XcdBarrier xcd_barrier_post(unsigned* bar, volatile LAS unsigned* st) {
    XcdBarrier b; b.bar = bar; b.x = xb_xcc_id(); b.st = st;
    if (threadIdx.x == 0) (void)xb_add(&bar[XB_XCNT(b.x)], 1u);
    return b;
}
__device__ __forceinline__ void xcd_barrier_complete(unsigned* bar, unsigned x, unsigned& nloc, unsigned& nx) {
    const unsigned G = gridDim.x * gridDim.y * gridDim.z;
    unsigned sum, cnt, mine, sp = 0u;
    for (;;) {
        sum = 0u; cnt = 0u; mine = 0u;
#pragma unroll
        for (unsigned j = 0; j < 16; ++j) { const unsigned c = xb_ld(&bar[XB_XCNT(j)]); sum += c; cnt += (c > 0u) ? 1u : 0u; mine = (j == x) ? c : mine; }
        if (sum == G) break;
        __builtin_amdgcn_s_sleep(1);
        if ((++sp & 255u) == 0u) { if (xb_ld(&bar[XB_TMO])) break; if (sp > XB_SPIN_CAP) { atomicAdd(&bar[XB_TMO], 1u); break; } }
    }
    nloc = mine > 0u ? mine : 1u; nx = cnt > 0u ? cnt : 1u;
}

__device__ __forceinline__ void xcd_barrier(const XcdBarrier& b) {
    asm volatile("s_waitcnt vmcnt(0)" ::: "memory");
    __syncthreads();
    if (threadIdx.x == 0) {
        unsigned* bar = b.bar;
        __builtin_amdgcn_s_waitcnt(0);
        unsigned nloc = b.st[0], nx = b.st[1];
        if (nloc == 0u) { xcd_barrier_complete(bar, b.x, nloc, nx); b.st[0] = nloc; b.st[1] = nx; }
        const unsigned old = xb_add(&bar[XB_XSUB(b.x)], 1u);
        const unsigned gen = old / nloc;
        if (old + 1u == (gen + 1u) * nloc) {
            __builtin_amdgcn_fence(__ATOMIC_RELEASE, "agent");
            asm volatile("s_waitcnt vmcnt(0)" ::: "memory");
            const unsigned og = xb_add(&bar[XB_TOP], 1u);
            const unsigned tg = og / nx;
            if (og + 1u == (tg + 1u) * nx) xb_add(&bar[XB_TOPGEN], 1u);
            else XB_SPIN(xb_ld(&bar[XB_TOPGEN]) == tg, bar);
            __builtin_amdgcn_fence(__ATOMIC_ACQUIRE, "agent");
            xb_add(&bar[XB_XGEN(b.x)], 1u);
            asm volatile("s_waitcnt vmcnt(0)" ::: "memory");
        } else {
            XB_SPIN(xb_ld(&bar[XB_XGEN(b.x)]) == gen, bar);
            __builtin_amdgcn_fence(__ATOMIC_ACQUIRE, "agent");
            asm volatile("s_waitcnt vmcnt(0)" ::: "memory");
        }
    }
    __syncthreads();
}

struct Params { const float* in[27]; float* out; unsigned char* ws; int ph_lo, ph_hi; };
enum { I_X = 0, I_WIN, I_GMNG, I_GMNB, I_GMWS, I_GMBS, I_CONVW, I_ALOG, I_DTB, I_GDNNG, I_MLIB, I_MLFB, I_MLNG, I_WBR, I_WOUT, I_LN1G, I_LN1B,
       I_WR, I_RB, I_WG, I_WU, I_WD, I_SG, I_SU, I_SD, I_LN2G, I_LN2B };

using pg8::f32x4; using pg8::u32x4; using pg8::Unit; using pg8::HALF; using pg8::BM;

struct MergeOrder {
    int G, c;
    __device__ bool next(int i, Unit& u) const {
        const long L = (long)(i >> 2) * G + c; if (L >= 256) return false;
        const int g = i & 3; int wgid = (int)L; { const int q = 256 / 8, xcd = wgid % 8, off = wgid / 8; wgid = xcd * q + off; }
        const int nN = 8, nig = 8 * nN, gid = wgid / nig, fm = gid * 8; const int pm = fm + ((wgid % nig) % 8), pn = (wgid % nig) / 8;
        u.pm = g * 32 + pm; u.pn = g * 8 + pn; return true;
    }
    __device__ __forceinline__ void a_ready(const Unit&) const {}
    __device__ __forceinline__ void done(const Unit&) const {}
};
struct EpiMerge {
    static constexpr bool PERM = true, AFTER_DRAIN = false;
    const bf16* Z; float* tmp; bf16* msum;
    __device__ __forceinline__ void operator()(const f32x4 (&acc)[2][2][4][2], const Unit& u, int wr, int wc, int fr, int fq) const {
        const int g = u.pm >> 5, pm = u.pm & 31, pn = u.pn & 7;
        const int row0 = pm * BM + wr * 64 + fr, col0 = pn * BM + wc * 32 + 8 * fq;
#pragma unroll
        for (int ai = 0; ai < 2; ++ai)
#pragma unroll
            for (int m = 0; m < 4; ++m) { const size_t row = (size_t)(row0 + ai * HALF + m * 16);
#pragma unroll
                for (int bj = 0; bj < 2; ++bj) { const int col = col0 + bj * HALF;
                    const v4u gr = *(const v4u*)(Z + row * ZC + ZC_GATE + g * D + col); float gl[8]; unpack8(gr, gl);
                    float* tp = tmp + row * D + col; f32x4 v0 = acc[ai][bj][m][0], v1 = acc[ai][bj][m][1];
#pragma unroll
                    for (int j = 0; j < 4; ++j) { v0[j] *= sigmoidf_(gl[j]); v1[j] *= sigmoidf_(gl[4 + j]); }
                    if (g > 0) { v0 += *(const f32x4*)tp; v1 += *(const f32x4*)(tp + 4); }
                    if (g < 3) { *(f32x4*)tp = v0; *(f32x4*)(tp + 4) = v1; }
                    else { u32x4 w; w.x = pk2(v0[0], v0[1]); w.y = pk2(v0[2], v0[3]); w.z = pk2(v1[0], v1[1]); w.w = pk2(v1[2], v1[3]); *(u32x4*)(msum + row * D + col) = w; } }
                asm volatile("" ::: "memory"); }
    }
};
struct EpiResid {
    static constexpr bool PERM = false, AFTER_DRAIN = false;
    const float* X; float* Y;
    __device__ __forceinline__ void operator()(const f32x4 (&acc)[2][2][4][2], const Unit& u, int wr, int wc, int fr, int fq) const {
        const int row0 = u.pm * BM + wr * 64 + fr, col0 = u.pn * BM + wc * 32 + 4 * fq;
#pragma unroll
        for (int ai = 0; ai < 2; ++ai)
#pragma unroll
            for (int m = 0; m < 4; ++m) { const size_t off = (size_t)(row0 + ai * HALF + m * 16) * D + col0;
#pragma unroll
                for (int bj = 0; bj < 2; ++bj)
#pragma unroll
                    for (int n = 0; n < 2; ++n) { const f32x4 xv = *(const f32x4*)(X + off + bj * HALF + n * 16); *(f32x4*)(Y + off + bj * HALF + n * 16) = xv * ALPHA + acc[ai][bj][m][n]; } }
    }
};
struct EpiGluDense {
    static constexpr bool PERM = true, AFTER_DRAIN = false;
    const float* comb; bf16* H;
    __device__ __forceinline__ void operator()(const f32x4 (&acc)[2][2][4][2], const Unit& u, int wr, int wc, int fr, int fq) const {
        const int e = u.pn >> 2, q = u.pn & 3; const int row0 = u.pm * BM + wr * 64 + fr, col0 = e * ED + q * 128 + wc * 32 + 8 * fq;
#pragma unroll
        for (int ai = 0; ai < 2; ++ai)
#pragma unroll
            for (int m = 0; m < 4; ++m) { const size_t row = (size_t)(row0 + ai * HALF + m * 16);
                const float c = (e < NE) ? comb[row * NE + e] : 1.f; float h[8];
#pragma unroll
                for (int n = 0; n < 2; ++n)
#pragma unroll
                    for (int j = 0; j < 4; ++j) h[4 * n + j] = siluf_(acc[ai][0][m][n][j]) * acc[ai][1][m][n][j] * c;
                u32x4 w; w.x = pk2(h[0], h[1]); w.y = pk2(h[2], h[3]); w.z = pk2(h[4], h[5]); w.w = pk2(h[6], h[7]);
                *(u32x4*)(H + row * HK + col0) = w; }
    }
};

__device__ __forceinline__ void tr_item(const float* src, size_t sld, bf16* dst, size_t dld, LAS float* scr, int lane) {
#pragma unroll 8
    for (int i = 0; i < 32; ++i) { const int kk = 2 * i + (lane >> 5); scr[kk * 33 + (lane & 31)] = src[(size_t)kk * sld + (lane & 31)]; }
    LDS_WAIT(); asm volatile("" ::: "memory");
    const int c = lane & 7;
#pragma unroll
    for (int j = 0; j < 4; ++j) { const int n = (lane >> 3) + 8 * j; const LAS float* s = scr + (8 * c) * 33 + n;
        v4u o; o.x = pk2(s[0 * 33], s[1 * 33]); o.y = pk2(s[2 * 33], s[3 * 33]); o.z = pk2(s[4 * 33], s[5 * 33]); o.w = pk2(s[6 * 33], s[7 * 33]);
        *(v4u*)(dst + (size_t)n * dld + 8 * c) = o; }
    LDS_WAIT(); asm volatile("" ::: "memory");
}
__device__ __forceinline__ void phase_convert(const Params& p, int l, LAS unsigned char* lds, int gw, int NGW, int wave, int lane) {
    unsigned char* ws = p.ws;
    const float* w_in = p.in[I_WIN] + (size_t)l * D * INC; const float* w_br = p.in[I_WBR] + (size_t)l * 4 * BW * D; const float* w_out = p.in[I_WOUT] + (size_t)l * D * D;
    const float* w_g = p.in[I_WG] + (size_t)l * NE * D * ED; const float* w_u = p.in[I_WU] + (size_t)l * NE * D * ED; const float* w_d = p.in[I_WD] + (size_t)l * NE * ED * D;
    const float* s_g = p.in[I_SG] + (size_t)l * D * ED; const float* s_u = p.in[I_SU] + (size_t)l * D * ED; const float* s_d = p.in[I_SD] + (size_t)l * ED * D;
    bf16* WIN = (bf16*)(ws + WS_WIN); bf16* WBR = (bf16*)(ws + WS_WBR); bf16* WOUT = (bf16*)(ws + WS_WOUT); bf16* WUP = (bf16*)(ws + WS_WUP); bf16* WDN = (bf16*)(ws + WS_WDN);
    LAS float* scr = (LAS float*)(lds + wave * 16384);
    constexpr int N_IN = (ZC / 32) * (D / 64), N_BR = 4 * (BW / 64) * (D / 32), N_OUT = (D / 64) * (D / 32), N_UP = NEX * 2 * (D / 64) * (ED / 32), N_DN = NEX * (ED / 64) * (D / 32);
    constexpr int NITEMS = N_IN + N_BR + N_OUT + N_UP + N_DN;
    for (int it = gw; it < NITEMS; it += NGW) {
        int r = it;
        if (r < N_IN) { const int kb = r / (ZC / 32), n0 = (r % (ZC / 32)) * 32, k0 = kb * 64; const int sc = n0 + (n0 >= ZC_GATE ? 16 : (n0 >= ZC_MLQ ? 8 : 0));
            tr_item(w_in + (size_t)k0 * INC + sc, INC, WIN + (size_t)n0 * D + k0, D, scr, lane); continue; } r -= N_IN;
        if (r < N_BR) { const int g = r / 512, rr = r % 512, k0 = (rr / 64) * 64, n0 = (rr % 64) * 32;
            tr_item(w_br + ((size_t)g * BW + k0) * D + n0, D, WBR + ((size_t)g * D + n0) * BW + k0, BW, scr, lane); continue; } r -= N_BR;
        if (r < N_OUT) { const int k0 = (r / 64) * 64, n0 = (r % 64) * 32;
            tr_item(w_out + (size_t)k0 * D + n0, D, WOUT + (size_t)n0 * D + k0, D, scr, lane); continue; } r -= N_OUT;
        if (r < N_UP) { const int e = r / 1024, rr = r % 1024, mat = rr / 512, r2 = rr % 512, k0 = (r2 / 16) * 64, n0 = (r2 % 16) * 32;
            const float* sb = (e < NE) ? ((mat ? w_u : w_g) + (size_t)e * D * ED) : (mat ? s_u : s_g);
            const int drow = e * 1024 + (n0 / 128) * 256 + mat * 128 + (n0 % 128);
            tr_item(sb + (size_t)k0 * ED + n0, ED, WUP + (size_t)drow * D + k0, D, scr, lane); continue; } r -= N_UP;
        { const int e = r / 512, rr = r % 512, k0 = (rr / 64) * 64, n0 = (rr % 64) * 32;
            const float* sb = (e < NE) ? (w_d + (size_t)e * ED * D) : s_d;
            tr_item(sb + (size_t)k0 * D + n0, D, WDN + (size_t)n0 * HK + e * ED + k0, HK, scr, lane); }
    }
}
__device__ __forceinline__ void phase_xprep(const Params& p, int l, const float* xin, LAS unsigned char* lds, int gw, int NGW, int tid, int lane) {
    const float* w_in = p.in[I_WIN] + (size_t)l * D * INC; LAS float* wsm = (LAS float*)lds;
    __syncthreads();
    for (int idx = tid; idx < D * 16; idx += 512) { const int d = idx >> 4, c = idx & 15; wsm[c * D + d] = w_in[(size_t)d * INC + (c < 8 ? 4608 + c : 6152 + (c - 8))]; }
    __syncthreads();
    bf16* XB = (bf16*)(p.ws + WS_XB); float* SMALL = (float*)(p.ws + WS_SMALL);
    for (int m = gw; m < T; m += NGW) {
        const v4f* xr = (const v4f*)(xin + (size_t)m * D) + lane; v4f v[8];
#pragma unroll
        for (int j = 0; j < 8; ++j) v[j] = xr[64 * j];
        v2u* xo = (v2u*)(XB + (size_t)m * D) + lane;
#pragma unroll
        for (int j = 0; j < 8; ++j) { v2u o; o.x = pk2(v[j].x, v[j].y); o.y = pk2(v[j].z, v[j].w); xo[64 * j] = o; }
        float res = 0.f;
#pragma unroll 1
        for (int c = 0; c < 16; ++c) { float a = 0.f;
#pragma unroll
            for (int j = 0; j < 8; ++j) { const v4f w = *(const LAS v4f*)(wsm + c * D + 4 * lane + 256 * j); a += v[j].x * w.x + v[j].y * w.y + v[j].z * w.z + v[j].w * w.w; }
            a = wave_sum(a); if (lane == c) res = a; }
        if (lane < 16) SMALL[(size_t)m * 16 + lane] = res;
    }
    __syncthreads();
}

__device__ __forceinline__ void phase_gdn_prep(const Params& p, int l, int gw, int NGW, int lane) {
    const bf16* Z = (const bf16*)(p.ws + WS_Z); const float* SMALL = (const float*)(p.ws + WS_SMALL);
    float* GQ = (float*)(p.ws + WS_GQ); float* GK = (float*)(p.ws + WS_GK); float* GV = (float*)(p.ws + WS_GV); float* EG = (float*)(p.ws + WS_EG); float* BETA = (float*)(p.ws + WS_BETA);
    const float* cw = p.in[I_CONVW] + (size_t)l * 4 * 1536;
    for (int t = gw; t < T; t += NGW) {
#pragma unroll
        for (int i = 0; i < 3; ++i) {
            float a[8];
#pragma unroll
            for (int e = 0; e < 8; ++e) a[e] = 0.f;
#pragma unroll
            for (int j = 0; j < 4; ++j) { const int tt = t - 3 + j; if (tt >= 0) {
                const v4u raw = *(const v4u*)(Z + (size_t)tt * ZC + ZC_GDN + i * 512 + 8 * lane); float x[8]; unpack8(raw, x);
                const v4f w0 = *(const v4f*)(cw + j * 1536 + i * 512 + 8 * lane), w1 = *(const v4f*)(cw + j * 1536 + i * 512 + 8 * lane + 4);
                a[0] += w0.x * x[0]; a[1] += w0.y * x[1]; a[2] += w0.z * x[2]; a[3] += w0.w * x[3]; a[4] += w1.x * x[4]; a[5] += w1.y * x[5]; a[6] += w1.z * x[6]; a[7] += w1.w * x[7]; } }
            float ss = 0.f;
#pragma unroll
            for (int e = 0; e < 8; ++e) { a[e] = siluf_(a[e]); ss += a[e] * a[e]; }
            if (i < 2) { ss = sum16(ss); const float r = rsqrtf(ss + 1e-6f) * (i == 0 ? 0.08838834764831845f : 1.f);
#pragma unroll
                for (int e = 0; e < 8; ++e) a[e] *= r; }
            float* dst = (i == 0 ? GQ : (i == 1 ? GK : GV)) + (size_t)t * BW + 8 * lane;
            *(v4f*)dst = (v4f){a[0], a[1], a[2], a[3]}; *(v4f*)(dst + 4) = (v4f){a[4], a[5], a[6], a[7]};
        }
        if (lane < 4) { const float b = SMALL[(size_t)t * 16 + lane], a = SMALL[(size_t)t * 16 + 4 + lane];
            const float g = -__expf(p.in[I_ALOG][l * 4 + lane]) * softplusf_(a + p.in[I_DTB][l * 4 + lane]);
            EG[(size_t)t * 4 + lane] = __expf(g); BETA[(size_t)t * 4 + lane] = sigmoidf_(b); }
    }
}

__device__ __forceinline__ void mixer_gdn_scan(const Params& p, LAS unsigned char* lds, int wgi, int tid, int wave, int lane) {
    const int h = wgi >> 1, half = wgi & 1, el = wave * 8 + (lane >> 3), j = lane & 7;
    const float* GQ = (const float*)(p.ws + WS_GQ); const float* GK = (const float*)(p.ws + WS_GK); const float* GV = (const float*)(p.ws + WS_GV);
    const float* EG = (const float*)(p.ws + WS_EG); const float* BETA = (const float*)(p.ws + WS_BETA); float* GO = (float*)(p.ws + WS_GO);
    LAS float* kb = (LAS float*)lds;
    LAS float* qb = (LAS float*)(lds + 32768);
    LAS float* vb = (LAS float*)(lds + 65536);
    LAS float* sb = (LAS float*)(lds + 81920);
    float S[16];
#pragma unroll
    for (int i = 0; i < 16; ++i) S[i] = 0.f;
    v4f rk[2], rq[2], rv; float rs = 0.f;
    auto gload = [&](int c) { const size_t t0 = (size_t)c * 32;
#pragma unroll
        for (int r = 0; r < 2; ++r) { const int idx = tid + 512 * r, tk = idx >> 5, c4 = idx & 31; rk[r] = *(const v4f*)(GK + (t0 + tk) * BW + h * 128 + 4 * c4); rq[r] = *(const v4f*)(GQ + (t0 + tk) * BW + h * 128 + 4 * c4); }
        { const int tk = tid >> 4, c4 = tid & 15; rv = *(const v4f*)(GV + (t0 + tk) * BW + h * 128 + half * 64 + 4 * c4); }
        if (tid < 32) rs = EG[(t0 + tid) * 4 + h]; else if (tid < 64) rs = BETA[(t0 + tid - 32) * 4 + h]; };
    auto lwrite = [&](int b) {
#pragma unroll
        for (int r = 0; r < 2; ++r) { const int idx = tid + 512 * r; *(LAS v4f*)(kb + b * 4096 + 4 * idx) = rk[r]; *(LAS v4f*)(qb + b * 4096 + 4 * idx) = rq[r]; }
        *(LAS v4f*)(vb + b * 2048 + 4 * tid) = rv; if (tid < 64) sb[b * 64 + tid] = rs; };
    gload(0); lwrite(0); __syncthreads();
    for (int c = 0; c < T / 32; ++c) {
        const int cur = c & 1;
        if (c + 1 < T / 32) gload(c + 1);
#pragma unroll 4
        for (int tk = 0; tk < 32; ++tk) {
            float k[16], q[16];
#pragma unroll
            for (int i = 0; i < 4; ++i) { const v4f a = *(const LAS v4f*)(kb + cur * 4096 + tk * 128 + 16 * j + 4 * i); k[4 * i] = a.x; k[4 * i + 1] = a.y; k[4 * i + 2] = a.z; k[4 * i + 3] = a.w;
                                          const v4f b = *(const LAS v4f*)(qb + cur * 4096 + tk * 128 + 16 * j + 4 * i); q[4 * i] = b.x; q[4 * i + 1] = b.y; q[4 * i + 2] = b.z; q[4 * i + 3] = b.w; }
            const float v = vb[cur * 2048 + tk * 64 + el], eg = sb[cur * 64 + tk], be = sb[cur * 64 + 32 + tk];
            float ks = 0.f;
#pragma unroll
            for (int i = 0; i < 16; ++i) ks += k[i] * S[i];
            ks = sum8(ks);
            const float vn = be * (v - eg * ks);
            float o = 0.f;
#pragma unroll
            for (int i = 0; i < 16; ++i) { S[i] = eg * S[i] + k[i] * vn; o += q[i] * S[i]; }
            o = sum8(o);
            if (j == 0) GO[((size_t)c * 32 + tk) * BW + h * 128 + half * 64 + el] = o;
        }
        if (c + 1 < T / 32) lwrite(cur ^ 1);
        __syncthreads();
    }
}
__device__ __forceinline__ void mixer_mlstm_scan(const Params& p, int l, LAS unsigned char* lds, int h, int tid, int wave, int lane) {
    const int e = wave * 16 + (lane >> 2), j = lane & 3;
    const bf16* Z = (const bf16*)(p.ws + WS_Z); const float* SMALL = (const float*)(p.ws + WS_SMALL); float* HO = (float*)(p.ws + WS_HO);
    const float ib = p.in[I_MLIB][l * 4 + h], fb = p.in[I_MLFB][l * 4 + h];
    LAS float* qb = (LAS float*)lds;
    LAS float* kb = (LAS float*)(lds + 16384);
    LAS float* vb = (LAS float*)(lds + 32768);
    LAS float* sb = (LAS float*)(lds + 65536);
    float Cm[16], nv[16];
#pragma unroll
    for (int i = 0; i < 16; ++i) { Cm[i] = 0.f; nv[i] = 0.f; }
    v4u rqk, rv; float rs = 0.f;
    auto gload = [&](int c) { const size_t t0 = (size_t)c * 32;
        { const int tt = tid & 255, tk = tt >> 3, c8 = tt & 7; rqk = *(const v4u*)(Z + (t0 + tk) * ZC + (tid < 256 ? ZC_MLQ : ZC_MLK) + h * 64 + 8 * c8); }
        { const int tk = tid >> 4, c8 = tid & 15; rv = *(const v4u*)(Z + (t0 + tk) * ZC + ZC_MLV + h * 128 + 8 * c8); }
        if (tid < 32) rs = sigmoidf_(SMALL[(t0 + tid) * 16 + 12 + h] + fb); else if (tid < 64) rs = __expf(SMALL[(t0 + tid - 32) * 16 + 8 + h] + ib); };
    auto lwrite = [&](int b) { float f[8];
        unpack8(rqk, f); { const int tt = tid & 255; const float sc = tid < 256 ? 0.125f : 1.f; LAS float* dst = (tid < 256 ? qb : kb) + b * 2048 + 8 * tt;
            *(LAS v4f*)dst = (v4f){f[0] * sc, f[1] * sc, f[2] * sc, f[3] * sc}; *(LAS v4f*)(dst + 4) = (v4f){f[4] * sc, f[5] * sc, f[6] * sc, f[7] * sc}; }
        unpack8(rv, f); { LAS float* dst = vb + b * 4096 + 8 * tid; *(LAS v4f*)dst = (v4f){f[0], f[1], f[2], f[3]}; *(LAS v4f*)(dst + 4) = (v4f){f[4], f[5], f[6], f[7]}; }
        if (tid < 64) sb[b * 64 + tid] = rs; };
    gload(0); lwrite(0); __syncthreads();
    for (int c = 0; c < T / 32; ++c) {
        const int cur = c & 1;
        if (c + 1 < T / 32) gload(c + 1);
#pragma unroll 4
        for (int tk = 0; tk < 32; ++tk) {
            float k[16], q[16];
#pragma unroll
            for (int i = 0; i < 4; ++i) { const v4f a = *(const LAS v4f*)(kb + cur * 2048 + tk * 64 + 16 * j + 4 * i); k[4 * i] = a.x; k[4 * i + 1] = a.y; k[4 * i + 2] = a.z; k[4 * i + 3] = a.w;
                                          const v4f b = *(const LAS v4f*)(qb + cur * 2048 + tk * 64 + 16 * j + 4 * i); q[4 * i] = b.x; q[4 * i + 1] = b.y; q[4 * i + 2] = b.z; q[4 * i + 3] = b.w; }
            const float v = vb[cur * 4096 + tk * 128 + e], f = sb[cur * 64 + tk], ig = sb[cur * 64 + 32 + tk];
            const float iv = ig * v; float num = 0.f, den = 0.f;
#pragma unroll
            for (int i = 0; i < 16; ++i) { Cm[i] = f * Cm[i] + iv * k[i]; nv[i] = f * nv[i] + ig * k[i]; num += q[i] * Cm[i]; den += q[i] * nv[i]; }
            num = sum4(num); den = sum4(den);
            if (j == 0) HO[((size_t)c * 32 + tk) * BW + h * 128 + e] = num / fmaxf(fabsf(den), 1.f);
        }
        if (c + 1 < T / 32) lwrite(cur ^ 1);
        __syncthreads();
    }
}
__device__ __forceinline__ void mixer_gmlp_item(const Params& p, int l, LAS unsigned char* lds, int item, int tid, int wave, int lane) {
    const int chunk = item >> 2, g = item & 3; const size_t tok0 = (size_t)chunk * 128;
    const bf16* Z = (const bf16*)(p.ws + WS_Z); bf16* BR1 = (bf16*)(p.ws + WS_BR) + (size_t)1 * T * BW;
    const float* ng = p.in[I_GMNG] + l * BW; const float* nb = p.in[I_GMNB] + l * BW;
    const float* wsp = p.in[I_GMWS] + ((size_t)(l * 4 + g) * 128) * 128; const float* bsp = p.in[I_GMBS] + (l * 4 + g) * 128;
    LAS float* vn = (LAS float*)lds;
    for (int r = 0; r < 16; ++r) { const int tk = wave * 16 + r;
        const v4u raw = *(const v4u*)(Z + (tok0 + tk) * ZC + ZC_GMV + 8 * lane); float x[8]; unpack8(raw, x); float s = 0.f;
#pragma unroll
        for (int i = 0; i < 8; ++i) { x[i] = gelu_tanh(x[i]); s += x[i]; }
        const float mean = wave_sum(s) * (1.f / 512.f); float ss = 0.f;
#pragma unroll
        for (int i = 0; i < 8; ++i) { x[i] -= mean; ss += x[i] * x[i]; }
        const float rstd = rsqrtf(wave_sum(ss) * (1.f / 512.f) + LN_EPS);
        if ((lane >> 4) == g) { const int cl = 8 * (lane & 15);
#pragma unroll
            for (int i = 0; i < 8; ++i) vn[tk * 128 + cl + i] = x[i] * rstd * ng[8 * lane + i] + nb[8 * lane + i]; }
    }
    __syncthreads();
    const int t = tid >> 2, cq = tid & 3; float acc[32];
#pragma unroll
    for (int i = 0; i < 32; ++i) acc[i] = 0.f;
    const float* wrow = wsp + (size_t)t * 128;
    for (int s = 0; s <= t; ++s) { const float w = wrow[s]; const LAS float* row = vn + s * 128 + cq * 32;
#pragma unroll
        for (int i4 = 0; i4 < 8; ++i4) { const v4f a = *(const LAS v4f*)(row + 4 * i4); acc[4 * i4] += w * a.x; acc[4 * i4 + 1] += w * a.y; acc[4 * i4 + 2] += w * a.z; acc[4 * i4 + 3] += w * a.w; } }
    const float bias = bsp[t];
#pragma unroll
    for (int i8 = 0; i8 < 4; ++i8) { const v4u raw = *(const v4u*)(Z + (tok0 + t) * ZC + ZC_GMU + g * 128 + cq * 32 + 8 * i8); float u[8]; unpack8(raw, u); float o[8];
#pragma unroll
        for (int i = 0; i < 8; ++i) o[i] = gelu_tanh(u[i]) * (acc[8 * i8 + i] + bias);
        v4u w; w.x = pk2(o[0], o[1]); w.y = pk2(o[2], o[3]); w.z = pk2(o[4], o[5]); w.w = pk2(o[6], o[7]);
        *(v4u*)(BR1 + (tok0 + t) * BW + g * 128 + cq * 32 + 8 * i8) = w; }
    __syncthreads();
}
__device__ __forceinline__ void mixer_sb_item(const Params& p, LAS float* qs  , int item, int lane) {
    const int h = item >> 11, t0 = (item & 2047) * 4;
    const bf16* Z = (const bf16*)(p.ws + WS_Z); bf16* BR0 = (bf16*)(p.ws + WS_BR);
#pragma unroll
    for (int qi = 0; qi < 4; ++qi) { const unsigned w = *(const unsigned*)(Z + (size_t)(t0 + qi) * ZC + ZC_SBQ + h * 128 + 2 * lane);
        qs[qi * 128 + 2 * lane] = bflo(w) * 0.08838834764831845f; qs[qi * 128 + 2 * lane + 1] = bfhi(w) * 0.08838834764831845f; }
    LDS_WAIT(); asm volatile("" ::: "memory");
    float acc[4][2], racc[4];
#pragma unroll
    for (int qi = 0; qi < 4; ++qi) { acc[qi][0] = 0.f; acc[qi][1] = 0.f; racc[qi] = 0.f; }
    for (int base = t0 + 2; base >= 0; base -= 64) {
        const int s = base - lane; const bool vk = s >= 0; const int sc = vk ? s : 0;
        float z[4] = {0.f, 0.f, 0.f, 0.f};
        const bf16* krow = Z + (size_t)sc * ZC + ZC_SBK + h * 128;
#pragma unroll 4
        for (int c = 0; c < 16; ++c) { const v4u raw = *(const v4u*)(krow + 8 * c); float kf[8]; unpack8(raw, kf);
#pragma unroll
            for (int qi = 0; qi < 4; ++qi) { const v4f q0 = *(const LAS v4f*)(qs + qi * 128 + 8 * c), q1 = *(const LAS v4f*)(qs + qi * 128 + 8 * c + 4);
                z[qi] += q0.x * kf[0] + q0.y * kf[1] + q0.z * kf[2] + q0.w * kf[3] + q1.x * kf[4] + q1.y * kf[5] + q1.z * kf[6] + q1.w * kf[7]; } }
        float a[4];
#pragma unroll
        for (int qi = 0; qi < 4; ++qi) { const bool m = vk && (s < t0 + qi); const float sp = m ? softplusf_(z[qi]) : 0.f;
            const float incl = wave_scan_incl(sp); const float tot = __builtin_bit_cast(float, __builtin_amdgcn_readlane(__builtin_bit_cast(int, incl), 63));
            a[qi] = m ? __expf(z[qi] - sp - (racc[qi] + (incl - sp))) : 0.f; racc[qi] += tot; }
#pragma unroll 8
        for (int kl = 0; kl < 64; ++kl) { int sk = base - kl; sk = sk < 0 ? 0 : sk;
            const unsigned w = *(const unsigned*)(Z + (size_t)sk * ZC + ZC_SBV + h * 128 + 2 * lane); const float v0 = bflo(w), v1 = bfhi(w);
#pragma unroll
            for (int qi = 0; qi < 4; ++qi) { const float aw = __builtin_bit_cast(float, __builtin_amdgcn_readlane(__builtin_bit_cast(int, a[qi]), kl)); acc[qi][0] += aw * v0; acc[qi][1] += aw * v1; } }
        if (fminf(fminf(racc[0], racc[1]), fminf(racc[2], racc[3])) > 104.f) break;
    }
#pragma unroll
    for (int qi = 0; qi < 4; ++qi) *(unsigned*)(BR0 + (size_t)(t0 + qi) * BW + h * 128 + 2 * lane) = pk2(acc[qi][0], acc[qi][1]);
}
__device__ __forceinline__ void phase_mixers(const Params& p, int l, LAS unsigned char* lds, int wg, int G, int tid, int wave, int lane) {
    if (wg < 8) { mixer_gdn_scan(p, lds, wg, tid, wave, lane); return; }
    if (wg < 12) { mixer_mlstm_scan(p, l, lds, wg - 8, tid, wave, lane); return; }
    const int w2 = wg - 12, G2 = G - 12;
    for (int it = w2; it < 256; it += G2) mixer_gmlp_item(p, l, lds, it, tid, wave, lane);
    LAS float* qs = (LAS float*)(lds + wave * 2048);
    for (int it = w2 * 8 + wave; it < 4 * 2048; it += G2 * 8) mixer_sb_item(p, qs, it, lane);
}

__device__ __forceinline__ void phase_post(const Params& p, int l, int gw, int NGW, int lane) {
    const bf16* Z = (const bf16*)(p.ws + WS_Z); const float* GO = (const float*)(p.ws + WS_GO); const float* HO = (const float*)(p.ws + WS_HO);
    bf16* BR2 = (bf16*)(p.ws + WS_BR) + (size_t)2 * T * BW; bf16* BR3 = (bf16*)(p.ws + WS_BR) + (size_t)3 * T * BW;
    const float* gng = p.in[I_GDNNG] + l * 128; const float* mng = p.in[I_MLNG] + l * BW;
    for (int t = gw; t < T; t += NGW) {
        {   const v4f a0 = *(const v4f*)(GO + (size_t)t * BW + 8 * lane), a1 = *(const v4f*)(GO + (size_t)t * BW + 8 * lane + 4); float o[8] = {a0.x, a0.y, a0.z, a0.w, a1.x, a1.y, a1.z, a1.w}; float ss = 0.f;
#pragma unroll
            for (int i = 0; i < 8; ++i) ss += o[i] * o[i];
            const float r = rsqrtf(sum16(ss) * (1.f / 128.f) + LN_EPS);
            const v4u graw = *(const v4u*)(Z + (size_t)t * ZC + ZC_GDNG + 8 * lane); float gt[8]; unpack8(graw, gt);
#pragma unroll
            for (int i = 0; i < 8; ++i) o[i] = o[i] * r * gng[(8 * lane + i) & 127] * siluf_(gt[i]);
            v4u w; w.x = pk2(o[0], o[1]); w.y = pk2(o[2], o[3]); w.z = pk2(o[4], o[5]); w.w = pk2(o[6], o[7]); *(v4u*)(BR2 + (size_t)t * BW + 8 * lane) = w; }
        {   const v4f a0 = *(const v4f*)(HO + (size_t)t * BW + 8 * lane), a1 = *(const v4f*)(HO + (size_t)t * BW + 8 * lane + 4); float o[8] = {a0.x, a0.y, a0.z, a0.w, a1.x, a1.y, a1.z, a1.w}; float ss = 0.f;
#pragma unroll
            for (int i = 0; i < 8; ++i) ss += o[i] * o[i];
            const float r = rsqrtf(sum16(ss) * (1.f / 128.f) + LN_EPS);
            const v4u graw = *(const v4u*)(Z + (size_t)t * ZC + ZC_MLO + 8 * lane); float gt[8]; unpack8(graw, gt);
#pragma unroll
            for (int i = 0; i < 8; ++i) o[i] = o[i] * r * mng[8 * lane + i] * sigmoidf_(gt[i]);
            v4u w; w.x = pk2(o[0], o[1]); w.y = pk2(o[2], o[3]); w.z = pk2(o[4], o[5]); w.w = pk2(o[6], o[7]); *(v4u*)(BR3 + (size_t)t * BW + 8 * lane) = w; }
    }
}

__device__ __forceinline__ void ln_row(const float* yrow, const float* g, const float* b, int lane, v4f (&v)[8]) {
    const v4f* yr = (const v4f*)yrow + lane; float s = 0.f;
#pragma unroll
    for (int j = 0; j < 8; ++j) { v[j] = yr[64 * j]; s += (v[j].x + v[j].y) + (v[j].z + v[j].w); }
    const float mean = wave_sum(s) * (1.f / D); float s2 = 0.f;
#pragma unroll
    for (int j = 0; j < 8; ++j) { v[j] = v[j] - mean; s2 += (v[j].x * v[j].x + v[j].y * v[j].y) + (v[j].z * v[j].z + v[j].w * v[j].w); }
    const float rstd = rsqrtf(wave_sum(s2) * (1.f / D) + LN_EPS);
#pragma unroll
    for (int j = 0; j < 8; ++j) { const v4f gg = ((const v4f*)g)[lane + 64 * j], bb = ((const v4f*)b)[lane + 64 * j]; v[j] = v[j] * rstd * gg + bb; }
}
__device__ __forceinline__ void phase_ln1_router(const Params& p, int l, LAS unsigned char* lds, int wg, int G, int wave, int lane) {
    const float* Y = (const float*)(p.ws + WS_Y); float* X1 = (float*)(p.ws + WS_X1); bf16* X1B = (bf16*)(p.ws + WS_X1B); float* COMB = (float*)(p.ws + WS_COMB);
    const float* g1 = p.in[I_LN1G] + (size_t)l * D; const float* b1 = p.in[I_LN1B] + (size_t)l * D;
    const float* wr = p.in[I_WR] + (size_t)l * D * NE; const float rbias = p.in[I_RB][l * NE + lane];
    LAS float* xt = (LAS float*)lds;
    LAS float* part = (LAS float*)(lds + 65536);
    for (int tl = wg; tl < T / 8; tl += G) {
        const size_t m = (size_t)tl * 8 + wave;
        {   v4f v[8]; ln_row(Y + m * D, g1, b1, lane, v);
            v4f* xo = (v4f*)(X1 + m * D) + lane; v2u* xb = (v2u*)(X1B + m * D) + lane;
#pragma unroll
            for (int j = 0; j < 8; ++j) { xo[64 * j] = v[j]; v2u o; o.x = pk2(v[j].x, v[j].y); o.y = pk2(v[j].z, v[j].w); xb[64 * j] = o; *(LAS v4f*)(xt + wave * D + 4 * lane + 256 * j) = v[j]; } }
        __syncthreads();
        {   float acc[8];
#pragma unroll
            for (int r = 0; r < 8; ++r) acc[r] = 0.f;
#pragma unroll 2
            for (int d4 = 0; d4 < 64; ++d4) { const int d = wave * 256 + 4 * d4;
                const float w0 = wr[(size_t)(d + 0) * NE + lane], w1 = wr[(size_t)(d + 1) * NE + lane], w2 = wr[(size_t)(d + 2) * NE + lane], w3 = wr[(size_t)(d + 3) * NE + lane];
#pragma unroll
                for (int r = 0; r < 8; ++r) { const v4f xv = *(const LAS v4f*)(xt + r * D + d); acc[r] += xv.x * w0 + xv.y * w1 + xv.z * w2 + xv.w * w3; } }
#pragma unroll
            for (int r = 0; r < 8; ++r) part[(wave * 8 + r) * 64 + lane] = acc[r]; }
        __syncthreads();
        {   float logit = 0.f;
#pragma unroll
            for (int w = 0; w < 8; ++w) logit += part[(w * 8 + wave) * 64 + lane];
            const float s = sigmoidf_(logit), biased = s + rbias;
            const float m1 = max8(biased); const float li = (float)(lane & 7);
            const float first = min8(biased == m1 ? li : 8.f);
            const float m2 = max8(li == first ? -INFINITY : biased);
            const float gs = m1 + m2; const int myg = lane >> 3; int grank = 0;
#pragma unroll
            for (int g2 = 0; g2 < 8; ++g2) { const float o = __builtin_bit_cast(float, __builtin_amdgcn_readlane(__builtin_bit_cast(int, gs), g2 * 8)); grank += (o > gs || (o == gs && g2 < myg)) ? 1 : 0; }
            const float masked = grank < 4 ? biased : -INFINITY; int rank = 0;
#pragma unroll
            for (int e2 = 0; e2 < 64; ++e2) { const float o = __builtin_bit_cast(float, __builtin_amdgcn_readlane(__builtin_bit_cast(int, masked), e2)); rank += (o > masked || (o == masked && e2 < lane)) ? 1 : 0; }
            const float wsel = rank < 6 ? s : 0.f; const float tot = wave_sum(wsel);
            COMB[m * NE + lane] = wsel / tot * 2.5f; }
        __syncthreads();
    }
}
__device__ __forceinline__ void phase_ln2(const Params& p, int l, float* dst, int gw, int NGW, int lane) {
    const float* Y = (const float*)(p.ws + WS_Y); const float* g2 = p.in[I_LN2G] + (size_t)l * D; const float* b2 = p.in[I_LN2B] + (size_t)l * D;
    for (int m = gw; m < T; m += NGW) { v4f v[8]; ln_row(Y + (size_t)m * D, g2, b2, lane, v); v4f* xo = (v4f*)(dst + (size_t)m * D) + lane;
#pragma unroll
        for (int j = 0; j < 8; ++j) xo[64 * j] = v[j]; }
}

constexpr int NPH = 11;
template <int l>
__device__ __forceinline__ void run_layer(const Params& p, LAS unsigned char* lds, const XcdBarrier& bar, int tid, int lane, int wave, int G, int wg, int gw, int NGW) {
    unsigned char* ws = p.ws;
    {
        const float* xin = (l == 0) ? p.in[I_X] : (const float*)(ws + WS_XCUR);
        float* xout = (l == NL - 1) ? p.out : (float*)(ws + WS_XCUR);
#ifndef PH_MASK
#define PH_MASK 0x7ff
#endif
#define RUN(k) (((PH_MASK >> (k)) & 1) && p.ph_lo <= l * NPH + (k) && l * NPH + (k) < p.ph_hi)
#define SEAM(k) do { if (l * NPH + (k) + 1 < p.ph_hi) xcd_barrier(bar); } while (0)
        if (RUN(0)) { phase_convert(p, l, lds, gw, NGW, wave, lane); phase_xprep(p, l, xin, lds, gw, NGW, tid, lane); SEAM(0); }
        if (RUN(1)) { pg8::Gemm g{(const bf16*)(ws + WS_XB), (const bf16*)(ws + WS_WIN), T, ZC, D, D, D}; pg8::StaticOrder S; S.init(T, ZC, G, wg);
            pg8::EpiBf16<0> E{(bf16*)(ws + WS_Z), ZC, nullptr, 0, 0, 1.f};
            pg8::gemm_phase<pg8::EpiBf16<0>, pg8::StaticOrder, true, true>(lds, g, S, E); SEAM(1); }
        if (RUN(2)) { phase_gdn_prep(p, l, gw, NGW, lane); SEAM(2); }
        if (RUN(3)) { phase_mixers(p, l, lds, wg, G, tid, wave, lane); SEAM(3); }
        if (RUN(4)) { phase_post(p, l, gw, NGW, lane); SEAM(4); }
        if (RUN(5)) { pg8::Gemm g{(const bf16*)(ws + WS_BR), (const bf16*)(ws + WS_WBR), 4 * T, 4 * D, BW, BW, BW}; MergeOrder S{G, wg};
            EpiMerge E{(const bf16*)(ws + WS_Z), (float*)(ws + WS_MTMP), (bf16*)(ws + WS_MSUM)};
            pg8::gemm_phase<EpiMerge, MergeOrder, true, true>(lds, g, S, E); SEAM(5); }
        if (RUN(6)) { pg8::Gemm g{(const bf16*)(ws + WS_MSUM), (const bf16*)(ws + WS_WOUT), T, D, D, D, D}; pg8::StaticOrder S; S.init(T, D, G, wg);
            EpiResid E{xin, (float*)(ws + WS_Y)};
            pg8::gemm_phase<EpiResid, pg8::StaticOrder, true, true>(lds, g, S, E); SEAM(6); }
        if (RUN(7)) { phase_ln1_router(p, l, lds, wg, G, wave, lane); SEAM(7); }
        if (RUN(8)) { pg8::Gemm g{(const bf16*)(ws + WS_X1B), (const bf16*)(ws + WS_WUP), T, NEX * 1024, D, D, D}; pg8::StaticOrder S; S.init(T, NEX * 1024, G, wg);
            EpiGluDense E{(const float*)(ws + WS_COMB), (bf16*)(ws + WS_HB)};
            pg8::gemm_phase<EpiGluDense, pg8::StaticOrder, true, true>(lds, g, S, E); SEAM(8); }
        if (RUN(9)) { pg8::Gemm g{(const bf16*)(ws + WS_HB), (const bf16*)(ws + WS_WDN), T, D, HK, HK, HK}; pg8::StaticOrder S; S.init(T, D, G, wg);
            EpiResid E{(const float*)(ws + WS_X1), (float*)(ws + WS_Y)};
            pg8::gemm_phase<EpiResid, pg8::StaticOrder, true, true>(lds, g, S, E); SEAM(9); }
        if (RUN(10)) { phase_ln2(p, l, xout, gw, NGW, lane); SEAM(10); }
#undef RUN
#undef SEAM
    }
}
__global__ void __launch_bounds__(512, 2) fwd_kernel(Params p) {
    extern __shared__ __attribute__((aligned(16))) unsigned char lds_raw[];
    LAS unsigned char* lds = (LAS unsigned char*)lds_raw;
    const int tid = threadIdx.x, lane = tid & 63, wave = __builtin_amdgcn_readfirstlane(tid >> 6);
    const int G = gridDim.x, wg = blockIdx.x, gw = wg * 8 + wave, NGW = G * 8;
    volatile LAS unsigned* MISC = (volatile LAS unsigned*)(lds + MISC_OFF);
    if (tid < 32) MISC[tid] = 0u;
    __syncthreads();
    unsigned* ctl = (unsigned*)(p.ws + WS_CTL);
    const bool multi = (p.ph_hi - p.ph_lo) > 1;
    XcdBarrier bar; bar.bar = ctl + CW_BAR; bar.x = 0; bar.st = nullptr;
    if (multi) bar = xcd_barrier_post(ctl + CW_BAR, MISC + 8);
    run_layer<0>(p, lds, bar, tid, lane, wave, G, wg, gw, NGW);
    run_layer<1>(p, lds, bar, tid, lane, wave, G, wg, gw, NGW);
}

#ifndef MK_MULTI_LAUNCH
#define MK_MULTI_LAUNCH 0
#endif
extern "C" void kernel_launch(void* const* d_in, const int* in_sizes, int n_in, void* d_out, int out_size, void* d_ws, size_t ws_size, hipStream_t stream) {
    static int grid = 0;
    if (grid == 0) {
        if (n_in != 27 || out_size != T * D || ws_size < WS_END) { fprintf(stderr, "kernel_launch: unexpected shapes (n_in %d out %d ws %zu need %zu)\n", n_in, out_size, ws_size, (size_t)WS_END); grid = -1; return; }
        int dev = 0, cus = 0, per_cu = 0;
        if (hipGetDevice(&dev) != hipSuccess || hipDeviceGetAttribute(&cus, hipDeviceAttributeMultiprocessorCount, dev) != hipSuccess) { grid = -1; return; }
        if (hipFuncSetAttribute((const void*)fwd_kernel, hipFuncAttributeMaxDynamicSharedMemorySize, LDS_BYTES) != hipSuccess) { fprintf(stderr, "kernel_launch: hipFuncSetAttribute failed\n"); grid = -1; return; }
        if (hipOccupancyMaxActiveBlocksPerMultiprocessor(&per_cu, (const void*)fwd_kernel, 512, LDS_BYTES) != hipSuccess || per_cu < 1) { fprintf(stderr, "kernel_launch: occupancy query says %d\n", per_cu); }
        (void)hipGetLastError();
        grid = cus;
    }
    if (grid < 0) return;
    (void)hipMemsetAsync((char*)d_ws + WS_CTL, 0, CTL_ZERO_BYTES, stream);
    Params p{};
    for (int i = 0; i < 27; ++i) p.in[i] = (const float*)d_in[i];
    p.out = (float*)d_out; p.ws = (unsigned char*)d_ws;
#if MK_MULTI_LAUNCH
    for (int ph = 0; ph < NL * NPH; ++ph) { p.ph_lo = ph; p.ph_hi = ph + 1; hipLaunchKernelGGL(fwd_kernel, dim3(grid), dim3(512), LDS_BYTES, stream, p); }
#else
    p.ph_lo = 0; p.ph_hi = NL * NPH; hipLaunchKernelGGL(fwd_kernel, dim3(grid), dim3(512), LDS_BYTES, stream, p);
#endif
}
```

```cpp
#include <hip/hip_runtime.h>
#include <cstdio>
#include <cstdint>
namespace pg8 {
#define PG8_LAS __attribute__((address_space(3)))
typedef unsigned short bf16_t;
typedef short bf16x8 __attribute__((ext_vector_type(8)));
typedef float f32x4 __attribute__((ext_vector_type(4)));
typedef unsigned u32x4 __attribute__((ext_vector_type(4)));
constexpr int BM = 256, BK = 64, HALF = 128, HTB = HALF * BK * 2  , STAGE_BYTES = 8 * HTB, NXCD = 8, WGM = 8;

__host__ __device__ __forceinline__ int lds_byte(int r, int c) { const int st = (r >> 4) * 2 + (c >> 5), rr = r & 15, cc = c & 31, ob = rr * 64 + cc * 2; return st * 1024 + (ob ^ (((ob >> 9) & 1) << 5)); }
__host__ __device__ __forceinline__ void stage_rc(int b, int& R, int& C) { const int st = b / 1024, sb = b % 1024, swz = sb ^ (((sb >> 9) & 1) << 5); R = (st >> 1) * 16 + swz / 64; C = (st & 1) * 32 + (swz % 64) / 2; }
__host__ __device__ __forceinline__ int perm32(int rho) { const int n = rho >> 4, i = rho & 15; return 8 * (i >> 2) + 4 * n + (i & 3); }

struct Unit { int pm, pn, aux; };
struct Gemm { const bf16_t* A; const bf16_t* Bt; int M, N, K, lda, ldb; };

struct StaticOrder {
    int nM, nN, nwg, G, c;
    __host__ __device__ void init(int M, int N, int G_, int c_) { nM = M / BM; nN = N / BM; nwg = nM * nN; G = G_; c = c_; }
    __host__ __device__ bool next(int i, Unit& u) const {
        const long L = (long)i * G + c; if (L >= nwg) return false;
        int wgid = (int)L; { const int q = nwg / NXCD, r = nwg % NXCD, xcd = wgid % NXCD, off = wgid / NXCD; wgid = (xcd < r ? xcd * (q + 1) : r * (q + 1) + (xcd - r) * q) + off; }
        const int nig = WGM * nN, gid = wgid / nig, fm = gid * WGM, gsz = (nM - fm) < WGM ? (nM - fm) : WGM;
        u.pm = fm + ((wgid % nig) % gsz); u.pn = (wgid % nig) / gsz; return true;
    }
    __device__ __forceinline__ void a_ready(const Unit&) const {}
    __device__ __forceinline__ void done(const Unit&) const {}
};

__device__ __forceinline__ unsigned cvt_pk_bf16(float lo, float hi) { unsigned r; asm volatile("v_cvt_pk_bf16_f32 %0, %1, %2" : "=v"(r) : "v"(lo), "v"(hi)); return r; }
typedef float f32x2 __attribute__((ext_vector_type(2)));
__device__ __forceinline__ f32x2 gelu_pk(f32x2 v) {
    const f32x2 av = __builtin_elementwise_abs(v), d = av * 0.2316418882f + 1.0f;
    f32x2 t; t.x = __builtin_amdgcn_rcpf(d.x); t.y = __builtin_amdgcn_rcpf(d.y);
    f32x2 q = t * 0.5307027145f + (-0.7265760135f); q = q * t + 0.7107068705f; q = q * t + (-0.142248368f); q = q * t + 0.127414796f; q = q * t;
    const f32x2 s = (v * v) * (-0.72134752044f);
    f32x2 e; e.x = __builtin_amdgcn_exp2f(s.x); e.y = __builtin_amdgcn_exp2f(s.y);
    const f32x2 m = v * (q * e), r = v - m;
    f32x2 o; o.x = v.x < 0.f ? m.x : r.x; o.y = v.y < 0.f ? m.y : r.y; return o;
}

template <int ACT  > struct EpiBf16 {
    static constexpr bool PERM = true, AFTER_DRAIN = false; static_assert(ACT == 0 || ACT == 1, "EpiBf16: ACT is 0 (none) or 1 (gelu_pk)");
    bf16_t* O; int ldc; const float* bias; int split_cols; size_t split_stride; float scale0;
    __device__ __forceinline__ void operator()(const f32x4 (&acc)[2][2][4][2], const Unit& u, int wr, int wc, int fr, int fq) const {
        const int row0 = u.pm * BM + wr * 64 + fr; int colt = u.pn * BM; bf16_t* base = O;
        float sc = 1.f; if (split_cols) { const int t = colt / split_cols; base += (size_t)t * split_stride; colt -= t * split_cols; if (t == 0) sc = scale0; }
        const int col0 = colt + wc * 32 + 8 * fq, bcol0 = u.pn * BM + wc * 32 + 8 * fq;
        f32x4 bv[2][2];
#pragma unroll
        for (int bj = 0; bj < 2; ++bj)
#pragma unroll
            for (int n = 0; n < 2; ++n) bv[bj][n] = bias ? *(const f32x4*)(bias + bcol0 + bj * HALF + 4 * n) : (f32x4){0.f, 0.f, 0.f, 0.f};
#pragma unroll
        for (int ai = 0; ai < 2; ++ai)
#pragma unroll
            for (int m = 0; m < 4; ++m) { bf16_t* rowp = base + (size_t)(row0 + ai * HALF + m * 16) * ldc + col0;
#pragma unroll
                for (int bj = 0; bj < 2; ++bj) { f32x4 v0 = acc[ai][bj][m][0] + bv[bj][0], v1 = acc[ai][bj][m][1] + bv[bj][1];
                    if (ACT == 1) { f32x2 a = gelu_pk((f32x2){v0[0], v0[1]}), b = gelu_pk((f32x2){v0[2], v0[3]}), c = gelu_pk((f32x2){v1[0], v1[1]}), d = gelu_pk((f32x2){v1[2], v1[3]});
                        v0 = (f32x4){a.x, a.y, b.x, b.y}; v1 = (f32x4){c.x, c.y, d.x, d.y}; }
                    v0 = v0 * sc; v1 = v1 * sc; u32x4 w; w.x = cvt_pk_bf16(v0[0], v0[1]); w.y = cvt_pk_bf16(v0[2], v0[3]); w.z = cvt_pk_bf16(v1[0], v1[1]); w.w = cvt_pk_bf16(v1[2], v1[3]);
                    *(u32x4*)(rowp + bj * HALF) = w; } }
    }
};

template <class Epi, class Sched, bool ALIGN_EPI = false, bool SP2 = false>
__device__ __forceinline__ void gemm_phase(PG8_LAS unsigned char* lds, const Gemm g, const Sched& S, const Epi& E) {
    const int tid = threadIdx.x, wid = __builtin_amdgcn_readfirstlane(tid >> 6), lane = tid & 63, wr = wid >> 2, wc = wid & 3, fr = lane & 15, fq = lane >> 4;
    const int K = g.K, nt = K / BK;
    unsigned voffA[2], voffB[2];
#pragma unroll
    for (int i = 0; i < 2; ++i) { int R, C; stage_rc(tid * 16 + i * 8192, R, C); const int Rb = Epi::PERM ? ((R & ~31) + perm32(R & 31)) : R;
        voffA[i] = (unsigned)(R * g.lda + C) * 2u; voffB[i] = (unsigned)(Rb * g.ldb + C) * 2u; }
    const size_t kstep = (size_t)(BK * 2);
    const size_t hstepA = (size_t)HALF * g.lda * 2, hstepB = (size_t)HALF * g.ldb * 2;
    const size_t tstepA = 2 * hstepA, tstepB = 2 * hstepB;
    const unsigned ldsw = (unsigned)wid * 1024u;
    const int aoff = lds_byte(wr * 64 + fr, fq * 8), boff = lds_byte(wc * 32 + fr, fq * 8);
#define PG8_SA(b, h) (((b) * 2 + (h)) * HTB)
#define PG8_SB(b, h) ((4 + (b) * 2 + (h)) * HTB)
#define PG8_STAGE(bufoff, gbase, voff) do { _Pragma("unroll") for (int _i = 0; _i < 2; ++_i) \
        __builtin_amdgcn_global_load_lds((const unsigned*)((const char*)(gbase) + (voff)[_i]), (PG8_LAS unsigned*)(lds + (bufoff) + ldsw + _i * 8192), 16, 0, 0); } while (0)
#define PG8_LDA(dst, b, h) do { _Pragma("unroll") for (int m = 0; m < 4; ++m) _Pragma("unroll") for (int k = 0; k < 2; ++k) dst[m][k] = *(const PG8_LAS bf16x8*)(lds + PG8_SA(b, h) + aoff + m * 2048 + k * 1024); } while (0)
#define PG8_LDB(dst, b, h) do { _Pragma("unroll") for (int n = 0; n < 2; ++n) _Pragma("unroll") for (int k = 0; k < 2; ++k) dst[n][k] = *(const PG8_LAS bf16x8*)(lds + PG8_SB(b, h) + boff + n * 2048 + k * 1024); } while (0)
#define PG8_MMA(ai, bj, At, Bt) do { __builtin_amdgcn_s_setprio(1); _Pragma("unroll") for (int m = 0; m < 4; ++m) _Pragma("unroll") for (int n = 0; n < 2; ++n) _Pragma("unroll") for (int k = 0; k < 2; ++k) \
        acc[ai][bj][m][n] = __builtin_amdgcn_mfma_f32_16x16x32_bf16(Bt[n][k], At[m][k], acc[ai][bj][m][n], 0, 0, 0); __builtin_amdgcn_s_setprio(0); } while (0)
#define PG8_WAIT_V(n) asm volatile("s_waitcnt vmcnt(" #n ")" ::: "memory")
#define PG8_WAIT_L(n) asm volatile("s_waitcnt lgkmcnt(" #n ")" ::: "memory")
#define PG8_BAR __builtin_amdgcn_s_barrier()
#define PG8_SCHED __builtin_amdgcn_sched_barrier(0)
    Unit cur, nxt; int ui = 0;
    if (!S.next(0, cur)) return;
    f32x4 acc[2][2][4][2];
#pragma unroll
    for (int a = 0; a < 2; ++a)
#pragma unroll
        for (int b = 0; b < 2; ++b)
#pragma unroll
            for (int m = 0; m < 4; ++m)
#pragma unroll
                for (int n = 0; n < 2; ++n) acc[a][b][m][n] = (f32x4){0.f, 0.f, 0.f, 0.f};
    bf16x8 At[4][2], B0[2][2], B1[2][2];
    const char* cA = (const char*)g.A + (size_t)cur.pm * tstepA; const char* cB = (const char*)g.Bt + (size_t)cur.pn * tstepB;
    S.a_ready(cur);
    if constexpr (SP2) {
        PG8_STAGE(PG8_SB(0, 0), cB, voffB); PG8_STAGE(PG8_SB(0, 1), cB + hstepB, voffB); PG8_STAGE(PG8_SA(0, 0), cA, voffA); PG8_STAGE(PG8_SA(0, 1), cA + hstepA, voffA);
        if (wr == 1) PG8_BAR;
        PG8_WAIT_V(2); PG8_BAR;
        PG8_STAGE(PG8_SB(1, 0), cB + kstep, voffB); PG8_STAGE(PG8_SA(1, 0), cA + kstep, voffA); PG8_STAGE(PG8_SB(1, 1), cB + hstepB + kstep, voffB);
        PG8_WAIT_V(6); PG8_BAR;
    } else {
        PG8_STAGE(PG8_SB(0, 0), cB, voffB); PG8_STAGE(PG8_SA(0, 0), cA, voffA); PG8_STAGE(PG8_SB(0, 1), cB + hstepB, voffB); PG8_STAGE(PG8_SA(0, 1), cA + hstepA, voffA);
        if (wr == 1) PG8_BAR;
        PG8_WAIT_V(4); PG8_BAR;
        PG8_STAGE(PG8_SB(1, 0), cB + kstep, voffB); PG8_STAGE(PG8_SA(1, 0), cA + kstep, voffA); PG8_STAGE(PG8_SB(1, 1), cB + hstepB + kstep, voffB);
        PG8_WAIT_V(6); PG8_BAR;
    }
    for (;;) {
        const bool has_next = S.next(ui + 1, nxt);
        const char* nA = has_next ? (const char*)g.A + (size_t)nxt.pm * tstepA : cA; const char* nB = has_next ? (const char*)g.Bt + (size_t)nxt.pn * tstepB : cB;
        for (int t = 0; t < nt; t += 2) {
            const bool last = (t == nt - 2);
            const char* a1 = cA + (size_t)(t + 1) * kstep;
            const char* a2 = last ? nA : cA + (size_t)(t + 2) * kstep; const char* b2 = last ? nB : cB + (size_t)(t + 2) * kstep;
            const char* a3 = a2 + kstep; const char* b3 = b2 + kstep;
            if (last && has_next) S.a_ready(nxt);
            if constexpr (SP2) {
            PG8_LDB(B0, 0, 0); PG8_LDB(B1, 0, 1); PG8_SCHED; PG8_LDA(At, 0, 0); PG8_STAGE(PG8_SA(1, 1), a1 + hstepA, voffA);
            PG8_WAIT_V(8); PG8_WAIT_L(0); PG8_BAR; PG8_MMA(0, 0, At, B0); PG8_MMA(0, 1, At, B1); PG8_BAR; PG8_SCHED;
            PG8_LDA(At, 0, 1); PG8_STAGE(PG8_SB(0, 0), b2, voffB); PG8_STAGE(PG8_SB(0, 1), b2 + hstepB, voffB); PG8_STAGE(PG8_SA(0, 0), a2, voffA);
            PG8_WAIT_V(8); PG8_WAIT_L(0); PG8_BAR; PG8_MMA(1, 0, At, B0); PG8_MMA(1, 1, At, B1); PG8_BAR; PG8_SCHED;
            PG8_LDB(B0, 1, 0); PG8_LDB(B1, 1, 1); PG8_SCHED; PG8_LDA(At, 1, 0); PG8_STAGE(PG8_SA(0, 1), a2 + hstepA, voffA);
            PG8_WAIT_V(8); PG8_WAIT_L(0); PG8_BAR; PG8_MMA(0, 0, At, B0); PG8_MMA(0, 1, At, B1); PG8_BAR; PG8_SCHED;
            PG8_LDA(At, 1, 1); PG8_STAGE(PG8_SB(1, 0), b3, voffB); PG8_STAGE(PG8_SB(1, 1), b3 + hstepB, voffB); PG8_STAGE(PG8_SA(1, 0), a3, voffA);
            PG8_WAIT_V(8); PG8_WAIT_L(0); PG8_BAR; PG8_MMA(1, 0, At, B0); PG8_MMA(1, 1, At, B1); PG8_BAR; PG8_SCHED;
            } else {
            PG8_LDB(B0, 0, 0); PG8_SCHED; PG8_LDA(At, 0, 0); PG8_STAGE(PG8_SA(1, 1), a1 + hstepA, voffA);
            PG8_WAIT_L(8); PG8_BAR; PG8_WAIT_L(0); PG8_MMA(0, 0, At, B0); PG8_BAR; PG8_SCHED;
            PG8_LDB(B1, 0, 1); PG8_STAGE(PG8_SB(0, 0), b2, voffB);
            PG8_BAR; PG8_WAIT_L(0); PG8_MMA(0, 1, At, B1); PG8_BAR;
            PG8_LDA(At, 0, 1); PG8_STAGE(PG8_SA(0, 0), a2, voffA);
            PG8_BAR; PG8_WAIT_L(0); PG8_MMA(1, 0, At, B0); PG8_BAR; PG8_SCHED;
            PG8_STAGE(PG8_SB(0, 1), b2 + hstepB, voffB);
            PG8_WAIT_V(6); PG8_BAR; PG8_MMA(1, 1, At, B1); PG8_BAR;
            PG8_LDB(B0, 1, 0); PG8_SCHED; PG8_LDA(At, 1, 0); PG8_STAGE(PG8_SA(0, 1), a2 + hstepA, voffA);
            PG8_WAIT_L(8); PG8_BAR; PG8_WAIT_L(0); PG8_MMA(0, 0, At, B0); PG8_BAR; PG8_SCHED;
            PG8_LDB(B1, 1, 1); PG8_STAGE(PG8_SB(1, 0), b3, voffB);
            PG8_BAR; PG8_WAIT_L(0); PG8_MMA(0, 1, At, B1); PG8_BAR;
            PG8_LDA(At, 1, 1); PG8_STAGE(PG8_SA(1, 0), a3, voffA);
            PG8_BAR; PG8_WAIT_L(0); PG8_MMA(1, 0, At, B0); PG8_BAR; PG8_SCHED;
            PG8_STAGE(PG8_SB(1, 1), b3 + hstepB, voffB);
            PG8_WAIT_V(6); PG8_BAR; PG8_MMA(1, 1, At, B1); PG8_BAR;
            }
        }
        if constexpr (ALIGN_EPI) { if (wr == 0) PG8_BAR; }
        if constexpr (!Epi::AFTER_DRAIN) { E(acc, cur, wr, wc, fr, fq); S.done(cur); }
        if (!has_next) break;
#pragma unroll
        for (int a = 0; a < 2; ++a)
#pragma unroll
            for (int b = 0; b < 2; ++b)
#pragma unroll
                for (int m = 0; m < 4; ++m)
#pragma unroll
                    for (int n = 0; n < 2; ++n) acc[a][b][m][n] = (f32x4){0.f, 0.f, 0.f, 0.f};
        cur = nxt; cA = nA; cB = nB; ++ui;
        if constexpr (ALIGN_EPI) { if (wr == 1) PG8_BAR; }
    }
    PG8_WAIT_V(0);
    if constexpr (!ALIGN_EPI) { if (wr == 0) PG8_BAR; }
    PG8_BAR;
    if constexpr (Epi::AFTER_DRAIN) { E.fused(acc, cur, wr, wc, fr, fq, lds, wid, lane); S.done(cur); }
#undef PG8_SA
#undef PG8_SB
#undef PG8_STAGE
#undef PG8_LDA
#undef PG8_LDB
#undef PG8_MMA
#undef PG8_WAIT_V
#undef PG8_WAIT_L
#undef PG8_BAR
#undef PG8_SCHED
}
template <class Epi, class Sched>
__device__ __forceinline__ void gemm_phase_gather(PG8_LAS unsigned char* lds, const Gemm g, const Sched& S, const Epi& E) {
    const int tid = threadIdx.x, wid = __builtin_amdgcn_readfirstlane(tid >> 6), lane = tid & 63, wr = wid >> 2, wc = wid & 3, fr = lane & 15, fq = lane >> 4;
    const int K = g.K, nt = K / BK;
    unsigned voffB[2]; int RA[2], CA[2];
#pragma unroll
    for (int i = 0; i < 2; ++i) { int R, C; stage_rc(tid * 16 + i * 8192, R, C); const int Rb = Epi::PERM ? ((R & ~31) + perm32(R & 31)) : R;
        RA[i] = R; CA[i] = C; voffB[i] = (unsigned)(Rb * g.ldb + C) * 2u; }
    const size_t kstep = (size_t)(BK * 2);
    const size_t hstepB = (size_t)HALF * g.ldb * 2, tstepB = 2 * hstepB;
    const unsigned ldsw = (unsigned)wid * 1024u;
    const int aoff = lds_byte(wr * 64 + fr, fq * 8), boff = lds_byte(wc * 32 + fr, fq * 8);
#define PG8_SA(b, h) (((b) * 2 + (h)) * HTB)
#define PG8_SB(b, h) ((4 + (b) * 2 + (h)) * HTB)
#define PG8_STAGE(bufoff, gbase, voff) do { _Pragma("unroll") for (int _i = 0; _i < 2; ++_i) \
        __builtin_amdgcn_global_load_lds((const unsigned*)((const char*)(gbase) + (voff)[_i]), (PG8_LAS unsigned*)(lds + (bufoff) + ldsw + _i * 8192), 16, 0, 0); } while (0)
#define PG8_LDA(dst, b, h) do { _Pragma("unroll") for (int m = 0; m < 4; ++m) _Pragma("unroll") for (int k = 0; k < 2; ++k) dst[m][k] = *(const PG8_LAS bf16x8*)(lds + PG8_SA(b, h) + aoff + m * 2048 + k * 1024); } while (0)
#define PG8_LDB(dst, b, h) do { _Pragma("unroll") for (int n = 0; n < 2; ++n) _Pragma("unroll") for (int k = 0; k < 2; ++k) dst[n][k] = *(const PG8_LAS bf16x8*)(lds + PG8_SB(b, h) + boff + n * 2048 + k * 1024); } while (0)
#define PG8_MMA(ai, bj, At, Bt) do { __builtin_amdgcn_s_setprio(1); _Pragma("unroll") for (int m = 0; m < 4; ++m) _Pragma("unroll") for (int n = 0; n < 2; ++n) _Pragma("unroll") for (int k = 0; k < 2; ++k) \
        acc[ai][bj][m][n] = __builtin_amdgcn_mfma_f32_16x16x32_bf16(Bt[n][k], At[m][k], acc[ai][bj][m][n], 0, 0, 0); __builtin_amdgcn_s_setprio(0); } while (0)
#define PG8_WAIT_V(n) asm volatile("s_waitcnt vmcnt(" #n ")" ::: "memory")
#define PG8_WAIT_L(n) asm volatile("s_waitcnt lgkmcnt(" #n ")" ::: "memory")
#define PG8_BAR __builtin_amdgcn_s_barrier()
#define PG8_SCHED __builtin_amdgcn_sched_barrier(0)
#define PG8_ROWS(dst, ui_) do { _Pragma("unroll") for (int _h = 0; _h < 2; ++_h) _Pragma("unroll") for (int _i = 0; _i < 2; ++_i) \
        dst[_h][_i] = (unsigned)S.row_token((ui_), _h * HALF + RA[_i]) * (unsigned)(g.lda * 2) + (unsigned)(CA[_i] * 2); } while (0)
    Unit cur, nxt; int ui = 0;
    if (!S.next(0, cur)) return;
    f32x4 acc[2][2][4][2];
#pragma unroll
    for (int a = 0; a < 2; ++a)
#pragma unroll
        for (int b = 0; b < 2; ++b)
#pragma unroll
            for (int m = 0; m < 4; ++m)
#pragma unroll
                for (int n = 0; n < 2; ++n) acc[a][b][m][n] = (f32x4){0.f, 0.f, 0.f, 0.f};
    bf16x8 At[4][2], B0[2][2], B1[2][2];
    unsigned offC[2][2];
    PG8_ROWS(offC, 0);
    const char* gA = (const char*)g.A;
    const char* cB = (const char*)g.Bt + (size_t)cur.pn * tstepB;
    PG8_STAGE(PG8_SB(0, 0), cB, voffB); PG8_STAGE(PG8_SB(0, 1), cB + hstepB, voffB); PG8_STAGE(PG8_SA(0, 0), gA, offC[0]); PG8_STAGE(PG8_SA(0, 1), gA, offC[1]);
    if (wr == 1) PG8_BAR;
    PG8_WAIT_V(2); PG8_BAR;
    PG8_STAGE(PG8_SB(1, 0), cB + kstep, voffB); PG8_STAGE(PG8_SA(1, 0), gA + kstep, offC[0]); PG8_STAGE(PG8_SB(1, 1), cB + hstepB + kstep, voffB);
    PG8_WAIT_V(6); PG8_BAR;
    for (;;) {
        const bool has_next = S.next(ui + 1, nxt);
        const char* nB = has_next ? (const char*)g.Bt + (size_t)nxt.pn * tstepB : cB;
        for (int t = 0; t < nt; t += 2) {
            const bool last = (t == nt - 2);
            const char* a1 = gA + (size_t)(t + 1) * kstep;
            const char* a2 = last ? gA : gA + (size_t)(t + 2) * kstep; const char* b2 = last ? nB : cB + (size_t)(t + 2) * kstep;
            const char* a3 = a2 + kstep; const char* b3 = b2 + kstep;
            PG8_LDB(B0, 0, 0); PG8_LDB(B1, 0, 1); PG8_SCHED; PG8_LDA(At, 0, 0); PG8_STAGE(PG8_SA(1, 1), a1, offC[1]);
            if (last && has_next) { PG8_ROWS(offC, ui + 1); }
            PG8_WAIT_V(8); PG8_WAIT_L(0); PG8_BAR; PG8_MMA(0, 0, At, B0); PG8_MMA(0, 1, At, B1); PG8_BAR; PG8_SCHED;
            PG8_LDA(At, 0, 1); PG8_STAGE(PG8_SB(0, 0), b2, voffB); PG8_STAGE(PG8_SB(0, 1), b2 + hstepB, voffB); PG8_STAGE(PG8_SA(0, 0), a2, offC[0]);
            PG8_WAIT_V(8); PG8_WAIT_L(0); PG8_BAR; PG8_MMA(1, 0, At, B0); PG8_MMA(1, 1, At, B1); PG8_BAR; PG8_SCHED;
            PG8_LDB(B0, 1, 0); PG8_LDB(B1, 1, 1); PG8_SCHED; PG8_LDA(At, 1, 0); PG8_STAGE(PG8_SA(0, 1), a2, offC[1]);
            PG8_WAIT_V(8); PG8_WAIT_L(0); PG8_BAR; PG8_MMA(0, 0, At, B0); PG8_MMA(0, 1, At, B1); PG8_BAR; PG8_SCHED;
            PG8_LDA(At, 1, 1); PG8_STAGE(PG8_SB(1, 0), b3, voffB); PG8_STAGE(PG8_SB(1, 1), b3 + hstepB, voffB); PG8_STAGE(PG8_SA(1, 0), a3, offC[0]);
            PG8_WAIT_V(8); PG8_WAIT_L(0); PG8_BAR; PG8_MMA(1, 0, At, B0); PG8_MMA(1, 1, At, B1); PG8_BAR; PG8_SCHED;
        }
        if (wr == 0) PG8_BAR;
        E(acc, cur, wr, wc, fr, fq); S.done(cur);
        if (!has_next) break;
#pragma unroll
        for (int a = 0; a < 2; ++a)
#pragma unroll
            for (int b = 0; b < 2; ++b)
#pragma unroll
                for (int m = 0; m < 4; ++m)
#pragma unroll
                    for (int n = 0; n < 2; ++n) acc[a][b][m][n] = (f32x4){0.f, 0.f, 0.f, 0.f};
        cur = nxt; cB = nB; ++ui;
        if (wr == 1) PG8_BAR;
    }
    PG8_WAIT_V(0);
    PG8_BAR;
#undef PG8_ROWS
#undef PG8_SA
#undef PG8_SB
#undef PG8_STAGE
#undef PG8_LDA
#undef PG8_LDB
#undef PG8_MMA
#undef PG8_WAIT_V
#undef PG8_WAIT_L
#undef PG8_BAR
#undef PG8_SCHED
}
}

constexpr int T = 8192, D = 2048, NL = 2, BW = 512, ZC = 14336, INC = 14352;
constexpr int NE = 64, NEX = 65  , ED = 512;
constexpr int HK = NEX * ED;
constexpr float ALPHA = 1.41421356237f;
constexpr float LN_EPS = 1e-5f;
constexpr int ZC_SBQ = 0, ZC_SBK = 512, ZC_SBV = 1024, ZC_GMU = 1536, ZC_GMV = 2048, ZC_GDN = 2560, ZC_GDNG = 4096,
              ZC_MLQ = 4608, ZC_MLK = 4864, ZC_MLV = 5120, ZC_MLO = 5632, ZC_GATE = 6144;

#define GAS __attribute__((address_space(1)))
#define LAS __attribute__((address_space(3)))
typedef unsigned short bf16;
typedef unsigned v4u __attribute__((ext_vector_type(4)));
typedef unsigned v2u __attribute__((ext_vector_type(2)));
typedef float v4f __attribute__((ext_vector_type(4)));
typedef float v2f __attribute__((ext_vector_type(2)));
#define LDS_WAIT() asm volatile("s_waitcnt lgkmcnt(0)" ::: "memory")

constexpr size_t MiB = 1u << 20;
constexpr size_t WS_CTL = 0, CTL_ZERO_BYTES = 1 * MiB;
constexpr size_t WS_WIN = 2 * MiB, WS_WBR = 58 * MiB, WS_WOUT = 66 * MiB, WS_WUP = 74 * MiB, WS_WDN = 334 * MiB;
constexpr size_t WS_XB = 464 * MiB, WS_SMALL = 496 * MiB, WS_EG = 497 * MiB, WS_BETA = WS_EG + 256 * 1024, WS_COMB = 498 * MiB;
constexpr size_t WS_Z = 500 * MiB, WS_GQ = 724 * MiB, WS_GK = 740 * MiB, WS_GV = 756 * MiB, WS_GO = 772 * MiB, WS_HO = 788 * MiB;
constexpr size_t WS_BR = 804 * MiB, WS_MTMP = 836 * MiB, WS_MSUM = 900 * MiB, WS_Y = 932 * MiB, WS_X1 = 996 * MiB, WS_X1B = 1060 * MiB;
constexpr size_t WS_XCUR = 1092 * MiB, WS_HB = 1156 * MiB, WS_YEXP = 1236 * MiB, WS_LIST = 1524 * MiB, WS_WL = 1526 * MiB, WS_SLOT = 1528 * MiB, WS_END = 1530 * MiB;
constexpr int HROWS = 73728;
static_assert(WS_HB + (size_t)HROWS * ED * 2 <= WS_YEXP && WS_YEXP + (size_t)HROWS * D * 2 <= WS_LIST, "ws map (moe)");
static_assert(WS_WIN + (size_t)ZC * D * 2 <= WS_WBR && WS_WUP + (size_t)NEX * 1024 * D * 2 <= WS_WDN && WS_WDN + (size_t)D * HK * 2 <= WS_XB, "ws map (weights)");
static_assert(WS_Z + (size_t)T * ZC * 2 <= WS_GQ, "ws map (acts)");
constexpr int CW_BAR = 4096, CW_CNT = 16384;
constexpr int TAB_OFF = 131072 + 1024;
constexpr int LDS_BYTES = 147456, MISC_OFF = 131072 + 320;

__device__ __forceinline__ float bflo(unsigned w) { return __uint_as_float(w << 16); }
__device__ __forceinline__ float bfhi(unsigned w) { return __uint_as_float(w & 0xffff0000u); }
__device__ __forceinline__ unsigned f2bf(float f) { unsigned u = __float_as_uint(f); return (u + 0x7fffu + ((u >> 16) & 1u)) >> 16; }
__device__ __forceinline__ unsigned pk2(float lo, float hi) { return f2bf(lo) | (f2bf(hi) << 16); }
template <int CTRL> __device__ __forceinline__ float dpp(float x) { return __builtin_bit_cast(float, __builtin_amdgcn_mov_dpp(__builtin_bit_cast(int, x), CTRL, 0xf, 0xf, true)); }
__device__ __forceinline__ float sum4(float x) { x += dpp<0xB1>(x); x += dpp<0x4E>(x); return x; }
__device__ __forceinline__ float sum8(float x) { x = sum4(x); x += dpp<0x141>(x); return x; }
__device__ __forceinline__ float sum16(float x) { x = sum8(x); x += dpp<0x140>(x); return x; }
__device__ __forceinline__ float wave_sum(float x) { x = sum16(x); x += __shfl_xor(x, 16); x += __shfl_xor(x, 32); return x; }
__device__ __forceinline__ float max8(float x) { x = fmaxf(x, dpp<0xB1>(x)); x = fmaxf(x, dpp<0x4E>(x)); x = fmaxf(x, dpp<0x141>(x)); return x; }
__device__ __forceinline__ float min8(float x) { x = fminf(x, dpp<0xB1>(x)); x = fminf(x, dpp<0x4E>(x)); x = fminf(x, dpp<0x141>(x)); return x; }
__device__ __forceinline__ float wave_scan_incl(float v) {
    v += __builtin_bit_cast(float, __builtin_amdgcn_update_dpp(0, __builtin_bit_cast(int, v), 0x111, 0xf, 0xf, true));
    v += __builtin_bit_cast(float, __builtin_amdgcn_update_dpp(0, __builtin_bit_cast(int, v), 0x112, 0xf, 0xf, true));
    v += __builtin_bit_cast(float, __builtin_amdgcn_update_dpp(0, __builtin_bit_cast(int, v), 0x114, 0xf, 0xf, true));
    v += __builtin_bit_cast(float, __builtin_amdgcn_update_dpp(0, __builtin_bit_cast(int, v), 0x118, 0xf, 0xf, true));
    v += __builtin_bit_cast(float, __builtin_amdgcn_update_dpp(0, __builtin_bit_cast(int, v), 0x142, 0xa, 0xf, false));
    v += __builtin_bit_cast(float, __builtin_amdgcn_update_dpp(0, __builtin_bit_cast(int, v), 0x143, 0xc, 0xf, false));
    return v;
}
__device__ __forceinline__ float sigmoidf_(float x) { return 1.f / (1.f + __expf(-x)); }
__device__ __forceinline__ float siluf_(float x) { return x / (1.f + __expf(-x)); }
__device__ __forceinline__ float softplusf_(float x) { return fmaxf(x, 0.f) + __logf(1.f + __expf(-fabsf(x))); }
__device__ __forceinline__ float gelu_tanh(float x) { const float y = 0.7978845608f * (x + 0.044715f * x * x * x); const float t = 1.f - 2.f / (__expf(2.f * y) + 1.f); return 0.5f * x * (1.f + t); }
__device__ __forceinline__ void unpack8(const v4u r, float (&f)[8]) { f[0] = bflo(r.x); f[1] = bfhi(r.x); f[2] = bflo(r.y); f[3] = bfhi(r.y); f[4] = bflo(r.z); f[5] = bfhi(r.z); f[6] = bflo(r.w); f[7] = bfhi(r.w); }
#define XB_TMO      128
#define XB_XCNT(j)  (256  + 64 * (j))
#define XB_XSUB(j)  (1280 + 64 * (j))
#define XB_XGEN(j)  (2304 + 64 * (j))
#define XB_TOP      3328
#define XB_TOPGEN   3392
#define XCD_BAR_WORDS 3456
#define XB_SPIN_CAP (1u << 18)

__device__ __forceinline__ unsigned xb_ld(unsigned* p)              { return __hip_atomic_load(p, __ATOMIC_RELAXED, __HIP_MEMORY_SCOPE_AGENT); }
__device__ __forceinline__ unsigned xb_add(unsigned* p, unsigned v) { return __hip_atomic_fetch_add(p, v, __ATOMIC_RELAXED, __HIP_MEMORY_SCOPE_AGENT); }
__device__ __forceinline__ unsigned xb_xcc_id() { return (unsigned)__builtin_amdgcn_s_getreg((3 << 11) | 20) & 0xFu; }
#define XB_SPIN(cond, bar) do { unsigned _sp = 0; while (cond) { __builtin_amdgcn_s_sleep(1); \
    if ((++_sp & 255u) == 0u) { if (xb_ld(&(bar)[XB_TMO])) break; if (_sp > XB_SPIN_CAP) { atomicAdd(&(bar)[XB_TMO], 1u); break; } } } } while (0)

struct XcdBarrier {
    unsigned* bar; unsigned x;
    volatile LAS unsigned* st;
};

__device__ __forceinline__ XcdBarrier xcd_barrier_post(unsigned* bar, volatile LAS unsigned* st) {
    XcdBarrier b; b.bar = bar; b.x = xb_xcc_id(); b.st = st;
    if (threadIdx.x == 0) (void)xb_add(&bar[XB_XCNT(b.x)], 1u);
    return b;
}
__device__ __forceinline__ void xcd_barrier_complete(unsigned* bar, unsigned x, unsigned& nloc, unsigned& nx) {
    const unsigned G = gridDim.x * gridDim.y * gridDim.z;
    unsigned sum, cnt, mine, sp = 0u;
    for (;;) {
        sum = 0u; cnt = 0u; mine = 0u;
#pragma unroll
        for (unsigned j = 0; j < 16; ++j) { const unsigned c = xb_ld(&bar[XB_XCNT(j)]); sum += c; cnt += (c > 0u) ? 1u : 0u; mine = (j == x) ? c : mine; }
        if (sum == G) break;
        __builtin_amdgcn_s_sleep(1);
        if ((++sp & 255u) == 0u) { if (xb_ld(&bar[XB_TMO])) break; if (sp > XB_SPIN_CAP) { atomicAdd(&bar[XB_TMO], 1u); break; } }
    }
    nloc = mine > 0u ? mine : 1u; nx = cnt > 0u ? cnt : 1u;
}

__device__ __forceinline__ void xcd_barrier(const XcdBarrier& b) {
    asm volatile("s_waitcnt vmcnt(0)" ::: "memory");
    __syncthreads();
    if (threadIdx.x == 0) {
        unsigned* bar = b.bar;
        __builtin_amdgcn_s_waitcnt(0);
        unsigned nloc = b.st[0], nx = b.st[1];
        if (nloc == 0u) { xcd_barrier_complete(bar, b.x, nloc, nx); b.st[0] = nloc; b.st[1] = nx; }
        const unsigned old = xb_add(&bar[XB_XSUB(b.x)], 1u);
        const unsigned gen = old / nloc;
        if (old + 1u == (gen + 1u) * nloc) {
            __builtin_amdgcn_fence(__ATOMIC_RELEASE, "agent");
            asm volatile("s_waitcnt vmcnt(0)" ::: "memory");
            const unsigned og = xb_add(&bar[XB_TOP], 1u);
            const unsigned tg = og / nx;
            if (og + 1u == (tg + 1u) * nx) xb_add(&bar[XB_TOPGEN], 1u);
            else XB_SPIN(xb_ld(&bar[XB_TOPGEN]) == tg, bar);
            __builtin_amdgcn_fence(__ATOMIC_ACQUIRE, "agent");
            xb_add(&bar[XB_XGEN(b.x)], 1u);
            asm volatile("s_waitcnt vmcnt(0)" ::: "memory");
        } else {
            XB_SPIN(xb_ld(&bar[XB_XGEN(b.x)]) == gen, bar);
            __builtin_amdgcn_fence(__ATOMIC_ACQUIRE, "agent");
            asm volatile("s_waitcnt vmcnt(0)" ::: "memory");
        }
    }
    __syncthreads();
}

struct Params { const float* in[27]; float* out; unsigned char* ws; int ph_lo, ph_hi; };
enum { I_X = 0, I_WIN, I_GMNG, I_GMNB, I_GMWS, I_GMBS, I_CONVW, I_ALOG, I_DTB, I_GDNNG, I_MLIB, I_MLFB, I_MLNG, I_WBR, I_WOUT, I_LN1G, I_LN1B,
       I_WR, I_RB, I_WG, I_WU, I_WD, I_SG, I_SU, I_SD, I_LN2G, I_LN2B };

using pg8::f32x4; using pg8::u32x4; using pg8::Unit; using pg8::HALF; using pg8::BM;

struct MergeOrder {
    int G, c;
    __device__ bool next(int i, Unit& u) const {
        const long L = (long)(i >> 2) * G + c; if (L >= 256) return false;
        const int g = i & 3; int wgid = (int)L; { const int q = 256 / 8, xcd = wgid % 8, off = wgid / 8; wgid = xcd * q + off; }
        const int nN = 8, nig = 8 * nN, gid = wgid / nig, fm = gid * 8; const int pm = fm + ((wgid % nig) % 8), pn = (wgid % nig) / 8;
        u.pm = g * 32 + pm; u.pn = g * 8 + pn; return true;
    }
    __device__ __forceinline__ void a_ready(const Unit&) const {}
    __device__ __forceinline__ void done(const Unit&) const {}
};
struct EpiMerge {
    static constexpr bool PERM = true, AFTER_DRAIN = false;
    const bf16* Z; float* tmp; bf16* msum;
    __device__ __forceinline__ void operator()(const f32x4 (&acc)[2][2][4][2], const Unit& u, int wr, int wc, int fr, int fq) const {
        const int g = u.pm >> 5, pm = u.pm & 31, pn = u.pn & 7;
        const int row0 = pm * BM + wr * 64 + fr, col0 = pn * BM + wc * 32 + 8 * fq;
#pragma unroll
        for (int ai = 0; ai < 2; ++ai)
#pragma unroll
            for (int m = 0; m < 4; ++m) { const size_t row = (size_t)(row0 + ai * HALF + m * 16);
#pragma unroll
                for (int bj = 0; bj < 2; ++bj) { const int col = col0 + bj * HALF;
                    const v4u gr = *(const v4u*)(Z + row * ZC + ZC_GATE + g * D + col); float gl[8]; unpack8(gr, gl);
                    float* tp = tmp + row * D + col; f32x4 v0 = acc[ai][bj][m][0], v1 = acc[ai][bj][m][1];
#pragma unroll
                    for (int j = 0; j < 4; ++j) { v0[j] *= sigmoidf_(gl[j]); v1[j] *= sigmoidf_(gl[4 + j]); }
                    if (g > 0) { v0 += *(const f32x4*)tp; v1 += *(const f32x4*)(tp + 4); }
                    if (g < 3) { *(f32x4*)tp = v0; *(f32x4*)(tp + 4) = v1; }
                    else { u32x4 w; w.x = pk2(v0[0], v0[1]); w.y = pk2(v0[2], v0[3]); w.z = pk2(v1[0], v1[1]); w.w = pk2(v1[2], v1[3]); *(u32x4*)(msum + row * D + col) = w; } }
                asm volatile("" ::: "memory"); }
    }
};
struct EpiResid {
    static constexpr bool PERM = false, AFTER_DRAIN = false;
    const float* X; float* Y;
    __device__ __forceinline__ void operator()(const f32x4 (&acc)[2][2][4][2], const Unit& u, int wr, int wc, int fr, int fq) const {
        const int row0 = u.pm * BM + wr * 64 + fr, col0 = u.pn * BM + wc * 32 + 4 * fq;
#pragma unroll
        for (int ai = 0; ai < 2; ++ai)
#pragma unroll
            for (int m = 0; m < 4; ++m) { const size_t off = (size_t)(row0 + ai * HALF + m * 16) * D + col0;
#pragma unroll
                for (int bj = 0; bj < 2; ++bj)
#pragma unroll
                    for (int n = 0; n < 2; ++n) { const f32x4 xv = *(const f32x4*)(X + off + bj * HALF + n * 16); *(f32x4*)(Y + off + bj * HALF + n * 16) = xv * ALPHA + acc[ai][bj][m][n]; } }
    }
};
struct MoeTab {
    LAS int* t; LAS unsigned short* tok; LAS float* wt; LAS unsigned char* mte;
    __device__ __forceinline__ MoeTab(LAS unsigned char* lds) : t((LAS int*)(lds + TAB_OFF)), tok((LAS unsigned short*)(lds + TAB_OFF + 1024)), wt((LAS float*)(lds + TAB_OFF + 5120)), mte((LAS unsigned char*)(lds + TAB_OFF + 13312)) {}
};
__device__ __forceinline__ void moe_tables(const MoeTab& M, const unsigned* cnt  , int tid, int lane, int wave) {
    __syncthreads();
    if (wave == 0) { const int c = (int)cnt[64 * lane]; const int tiles = (c + 255) >> 8; const float incl = wave_scan_incl((float)tiles);
        M.t[80 + lane] = c; M.t[lane] = (int)incl - tiles; if (lane == 63) { M.t[64] = (int)incl; M.t[65] = (int)incl + T / 256; M.t[80 + 64] = T; } }
    __syncthreads();
    const int Mt = M.t[65];
    for (int mt = tid; mt < Mt; mt += 512) { int e = 0;
        for (int k = 1; k <= 64; ++k) e = (M.t[k] <= mt) ? k : e;
        M.mte[mt] = (unsigned char)e; }
    __syncthreads();
}
struct UpOrder {
    MoeTab M; int n;
    __device__ __forceinline__ bool next(int i, Unit& u) const { if (i >= n) return false; u.pm = M.t[168 + i]; u.pn = M.t[176 + i]; u.aux = i; return true; }
    __device__ __forceinline__ int row_token(int i, int r) const { return (int)M.tok[i * 256 + r]; }
    __device__ __forceinline__ void a_ready(const Unit&) const {}
    __device__ __forceinline__ void done(const Unit&) const {}
};
__device__ __forceinline__ int up_order_build(const MoeTab& M, const int* LIST, const float* WL, int wg, int G, int tid) {
    const int U = 4 * M.t[65];
    if (tid < 8) { const int L = tid * G + wg; if (L < U) { const int mt = L >> 2, q = L & 3, e = M.mte[mt]; M.t[168 + tid] = mt; M.t[176 + tid] = e * 4 + q; M.t[184 + tid] = e; M.t[192 + tid] = mt - M.t[e]; } }
    int n = 0;
#pragma unroll
    for (int i = 0; i < 8; ++i) n += (i * G + wg < U) ? 1 : 0;
    __syncthreads();
    for (int idx = tid; idx < n * 256; idx += 512) { const int i = idx >> 8, r = idx & 255, e = M.t[184 + i], li = M.t[192 + i] * 256 + r;
        int tk = 0; float w = 0.f;
        if (e < NE) { if (li < M.t[80 + e]) { tk = LIST[e * T + li]; w = WL[e * T + li]; } } else { tk = li; w = 1.f; }
        M.tok[idx] = (unsigned short)tk; M.wt[idx] = w; }
    __syncthreads();
    return n;
}
struct EpiGluSparse {
    static constexpr bool PERM = true, AFTER_DRAIN = false;
    LAS const float* wt; bf16* H;
    __device__ __forceinline__ void operator()(const f32x4 (&acc)[2][2][4][2], const Unit& u, int wr, int wc, int fr, int fq) const {
        const int q = u.pn & 3; const int rl0 = wr * 64 + fr, col0 = q * 128 + wc * 32 + 8 * fq;
#pragma unroll
        for (int ai = 0; ai < 2; ++ai)
#pragma unroll
            for (int m = 0; m < 4; ++m) { const int rl = rl0 + ai * HALF + m * 16; const float c = wt[u.aux * 256 + rl]; float h[8];
#pragma unroll
                for (int n = 0; n < 2; ++n)
#pragma unroll
                    for (int j = 0; j < 4; ++j) h[4 * n + j] = siluf_(acc[ai][0][m][n][j]) * acc[ai][1][m][n][j] * c;
                u32x4 w; w.x = pk2(h[0], h[1]); w.y = pk2(h[2], h[3]); w.z = pk2(h[4], h[5]); w.w = pk2(h[6], h[7]);
                *(u32x4*)(H + ((size_t)u.pm * 256 + rl) * ED + col0) = w; }
    }
};
struct DownOrder {
    MoeTab M; int G, c, U;
    __device__ __forceinline__ bool next(int i, Unit& u) const { const int L = i * G + c; if (L >= U) return false; const int mt = L >> 3; u.pm = mt; u.pn = (int)M.mte[mt] * 8 + (L & 7); u.aux = 0; return true; }
    __device__ __forceinline__ void a_ready(const Unit&) const {}
    __device__ __forceinline__ void done(const Unit&) const {}
};
struct EpiYexp {
    static constexpr bool PERM = true, AFTER_DRAIN = false;
    bf16* Y;
    __device__ __forceinline__ void operator()(const f32x4 (&acc)[2][2][4][2], const Unit& u, int wr, int wc, int fr, int fq) const {
        const int row0 = u.pm * BM + wr * 64 + fr, col0 = (u.pn & 7) * BM + wc * 32 + 8 * fq;
#pragma unroll
        for (int ai = 0; ai < 2; ++ai)
#pragma unroll
            for (int m = 0; m < 4; ++m) { bf16* rowp = Y + (size_t)(row0 + ai * HALF + m * 16) * D + col0;
#pragma unroll
                for (int bj = 0; bj < 2; ++bj) { const f32x4 v0 = acc[ai][bj][m][0], v1 = acc[ai][bj][m][1];
                    u32x4 w; w.x = pk2(v0[0], v0[1]); w.y = pk2(v0[2], v0[3]); w.z = pk2(v1[0], v1[1]); w.w = pk2(v1[2], v1[3]); *(u32x4*)(rowp + bj * HALF) = w; } }
    }
};

__device__ __forceinline__ void tr_item(const float* src, size_t sld, bf16* dst, size_t dld, LAS float* scr, int lane) {
#pragma unroll 8
    for (int i = 0; i < 32; ++i) { const int kk = 2 * i + (lane >> 5); scr[kk * 33 + (lane & 31)] = src[(size_t)kk * sld + (lane & 31)]; }
    LDS_WAIT(); asm volatile("" ::: "memory");
    const int c = lane & 7;
#pragma unroll
    for (int j = 0; j < 4; ++j) { const int n = (lane >> 3) + 8 * j; const LAS float* s = scr + (8 * c) * 33 + n;
        v4u o; o.x = pk2(s[0 * 33], s[1 * 33]); o.y = pk2(s[2 * 33], s[3 * 33]); o.z = pk2(s[4 * 33], s[5 * 33]); o.w = pk2(s[6 * 33], s[7 * 33]);
        *(v4u*)(dst + (size_t)n * dld + 8 * c) = o; }
    LDS_WAIT(); asm volatile("" ::: "memory");
}
__device__ __forceinline__ void phase_convert(const Params& p, int l, LAS unsigned char* lds, int gw, int NGW, int wave, int lane) {
    unsigned char* ws = p.ws;
    const float* w_in = p.in[I_WIN] + (size_t)l * D * INC; const float* w_br = p.in[I_WBR] + (size_t)l * 4 * BW * D; const float* w_out = p.in[I_WOUT] + (size_t)l * D * D;
    const float* w_g = p.in[I_WG] + (size_t)l * NE * D * ED; const float* w_u = p.in[I_WU] + (size_t)l * NE * D * ED; const float* w_d = p.in[I_WD] + (size_t)l * NE * ED * D;
    const float* s_g = p.in[I_SG] + (size_t)l * D * ED; const float* s_u = p.in[I_SU] + (size_t)l * D * ED; const float* s_d = p.in[I_SD] + (size_t)l * ED * D;
    bf16* WIN = (bf16*)(ws + WS_WIN); bf16* WBR = (bf16*)(ws + WS_WBR); bf16* WOUT = (bf16*)(ws + WS_WOUT); bf16* WUP = (bf16*)(ws + WS_WUP); bf16* WDN = (bf16*)(ws + WS_WDN);
    LAS float* scr = (LAS float*)(lds + wave * 16384);
    constexpr int N_IN = (ZC / 32) * (D / 64), N_BR = 4 * (BW / 64) * (D / 32), N_OUT = (D / 64) * (D / 32), N_UP = NEX * 2 * (D / 64) * (ED / 32), N_DN = NEX * (ED / 64) * (D / 32);
    constexpr int NITEMS = N_IN + N_BR + N_OUT + N_UP + N_DN;
    for (int it = gw; it < NITEMS; it += NGW) {
        int r = it;
        if (r < N_IN) { const int kb = r / (ZC / 32), n0 = (r % (ZC / 32)) * 32, k0 = kb * 64; const int sc = n0 + (n0 >= ZC_GATE ? 16 : (n0 >= ZC_MLQ ? 8 : 0));
            tr_item(w_in + (size_t)k0 * INC + sc, INC, WIN + (size_t)n0 * D + k0, D, scr, lane); continue; } r -= N_IN;
        if (r < N_BR) { const int g = r / 512, rr = r % 512, k0 = (rr / 64) * 64, n0 = (rr % 64) * 32;
            tr_item(w_br + ((size_t)g * BW + k0) * D + n0, D, WBR + ((size_t)g * D + n0) * BW + k0, BW, scr, lane); continue; } r -= N_BR;
        if (r < N_OUT) { const int k0 = (r / 64) * 64, n0 = (r % 64) * 32;
            tr_item(w_out + (size_t)k0 * D + n0, D, WOUT + (size_t)n0 * D + k0, D, scr, lane); continue; } r -= N_OUT;
        if (r < N_UP) { const int e = r / 1024, rr = r % 1024, mat = rr / 512, r2 = rr % 512, k0 = (r2 / 16) * 64, n0 = (r2 % 16) * 32;
            const float* sb = (e < NE) ? ((mat ? w_u : w_g) + (size_t)e * D * ED) : (mat ? s_u : s_g);
            const int drow = e * 1024 + (n0 / 128) * 256 + mat * 128 + (n0 % 128);
            tr_item(sb + (size_t)k0 * ED + n0, ED, WUP + (size_t)drow * D + k0, D, scr, lane); continue; } r -= N_UP;
        { const int e = r / 512, rr = r % 512, k0 = (rr / 64) * 64, n0 = (rr % 64) * 32;
            const float* sb = (e < NE) ? (w_d + (size_t)e * ED * D) : s_d;
            tr_item(sb + (size_t)k0 * D + n0, D, WDN + ((size_t)e * D + n0) * ED + k0, ED, scr, lane); }
    }
}
__device__ __forceinline__ void phase_xprep(const Params& p, int l, const float* xin, LAS unsigned char* lds, int gw, int NGW, int tid, int lane) {
    const float* w_in = p.in[I_WIN] + (size_t)l * D * INC; LAS float* wsm = (LAS float*)lds;
    __syncthreads();
    for (int idx = tid; idx < D * 16; idx += 512) { const int d = idx >> 4, c = idx & 15; wsm[c * D + d] = w_in[(size_t)d * INC + (c < 8 ? 4608 + c : 6152 + (c - 8))]; }
    __syncthreads();
    bf16* XB = (bf16*)(p.ws + WS_XB); float* SMALL = (float*)(p.ws + WS_SMALL);
    for (int m = gw; m < T; m += NGW) {
        const v4f* xr = (const v4f*)(xin + (size_t)m * D) + lane; v4f v[8];
#pragma unroll
        for (int j = 0; j < 8; ++j) v[j] = xr[64 * j];
        v2u* xo = (v2u*)(XB + (size_t)m * D) + lane;
#pragma unroll
        for (int j = 0; j < 8; ++j) { v2u o; o.x = pk2(v[j].x, v[j].y); o.y = pk2(v[j].z, v[j].w); xo[64 * j] = o; }
        float res = 0.f;
#pragma unroll 1
        for (int c = 0; c < 16; ++c) { float a = 0.f;
#pragma unroll
            for (int j = 0; j < 8; ++j) { const v4f w = *(const LAS v4f*)(wsm + c * D + 4 * lane + 256 * j); a += v[j].x * w.x + v[j].y * w.y + v[j].z * w.z + v[j].w * w.w; }
            a = wave_sum(a); if (lane == c) res = a; }
        if (lane < 16) SMALL[(size_t)m * 16 + lane] = res;
    }
    __syncthreads();
}

__device__ __forceinline__ void phase_gdn_prep(const Params& p, int l, int gw, int NGW, int lane) {
    const bf16* Z = (const bf16*)(p.ws + WS_Z); const float* SMALL = (const float*)(p.ws + WS_SMALL);
    float* GQ = (float*)(p.ws + WS_GQ); float* GK = (float*)(p.ws + WS_GK); float* GV = (float*)(p.ws + WS_GV); float* EG = (float*)(p.ws + WS_EG); float* BETA = (float*)(p.ws + WS_BETA);
    const float* cw = p.in[I_CONVW] + (size_t)l * 4 * 1536;
    for (int t = gw; t < T; t += NGW) {
#pragma unroll
        for (int i = 0; i < 3; ++i) {
            float a[8];
#pragma unroll
            for (int e = 0; e < 8; ++e) a[e] = 0.f;
#pragma unroll
            for (int j = 0; j < 4; ++j) { const int tt = t - 3 + j; if (tt >= 0) {
                const v4u raw = *(const v4u*)(Z + (size_t)tt * ZC + ZC_GDN + i * 512 + 8 * lane); float x[8]; unpack8(raw, x);
                const v4f w0 = *(const v4f*)(cw + j * 1536 + i * 512 + 8 * lane), w1 = *(const v4f*)(cw + j * 1536 + i * 512 + 8 * lane + 4);
                a[0] += w0.x * x[0]; a[1] += w0.y * x[1]; a[2] += w0.z * x[2]; a[3] += w0.w * x[3]; a[4] += w1.x * x[4]; a[5] += w1.y * x[5]; a[6] += w1.z * x[6]; a[7] += w1.w * x[7]; } }
            float ss = 0.f;
#pragma unroll
            for (int e = 0; e < 8; ++e) { a[e] = siluf_(a[e]); ss += a[e] * a[e]; }
            if (i < 2) { ss = sum16(ss); const float r = rsqrtf(ss + 1e-6f) * (i == 0 ? 0.08838834764831845f : 1.f);
#pragma unroll
                for (int e = 0; e < 8; ++e) a[e] *= r; }
            float* dst = (i == 0 ? GQ : (i == 1 ? GK : GV)) + (size_t)t * BW + 8 * lane;
            *(v4f*)dst = (v4f){a[0], a[1], a[2], a[3]}; *(v4f*)(dst + 4) = (v4f){a[4], a[5], a[6], a[7]};
        }
        if (lane < 4) { const float b = SMALL[(size_t)t * 16 + lane], a = SMALL[(size_t)t * 16 + 4 + lane];
            const float g = -__expf(p.in[I_ALOG][l * 4 + lane]) * softplusf_(a + p.in[I_DTB][l * 4 + lane]);
            EG[(size_t)t * 4 + lane] = __expf(g); BETA[(size_t)t * 4 + lane] = sigmoidf_(b); }
    }
}

__device__ __forceinline__ void mixer_gdn_scan(const Params& p, LAS unsigned char* lds, int wgi, int tid, int wave, int lane) {
    const int h = wgi >> 1, half = wgi & 1, el = wave * 8 + (lane >> 3), j = lane & 7;
    const float* GQ = (const float*)(p.ws + WS_GQ); const float* GK = (const float*)(p.ws + WS_GK); const float* GV = (const float*)(p.ws + WS_GV);
    const float* EG = (const float*)(p.ws + WS_EG); const float* BETA = (const float*)(p.ws + WS_BETA); float* GO = (float*)(p.ws + WS_GO);
    LAS float* kb = (LAS float*)lds;
    LAS float* qb = (LAS float*)(lds + 32768);
    LAS float* vb = (LAS float*)(lds + 65536);
    LAS float* sb = (LAS float*)(lds + 81920);
    float S[16];
#pragma unroll
    for (int i = 0; i < 16; ++i) S[i] = 0.f;
    v4f rk[2], rq[2], rv; float rs = 0.f;
    auto gload = [&](int c) { const size_t t0 = (size_t)c * 32;
#pragma unroll
        for (int r = 0; r < 2; ++r) { const int idx = tid + 512 * r, tk = idx >> 5, c4 = idx & 31; rk[r] = *(const v4f*)(GK + (t0 + tk) * BW + h * 128 + 4 * c4); rq[r] = *(const v4f*)(GQ + (t0 + tk) * BW + h * 128 + 4 * c4); }
        { const int tk = tid >> 4, c4 = tid & 15; rv = *(const v4f*)(GV + (t0 + tk) * BW + h * 128 + half * 64 + 4 * c4); }
        if (tid < 32) rs = EG[(t0 + tid) * 4 + h]; else if (tid < 64) rs = BETA[(t0 + tid - 32) * 4 + h]; };
    auto lwrite = [&](int b) {
#pragma unroll
        for (int r = 0; r < 2; ++r) { const int idx = tid + 512 * r; *(LAS v4f*)(kb + b * 4096 + 4 * idx) = rk[r]; *(LAS v4f*)(qb + b * 4096 + 4 * idx) = rq[r]; }
        *(LAS v4f*)(vb + b * 2048 + 4 * tid) = rv; if (tid < 64) sb[b * 64 + tid] = rs; };
    gload(0); lwrite(0); __syncthreads();
    for (int c = 0; c < T / 32; ++c) {
        const int cur = c & 1;
        if (c + 1 < T / 32) gload(c + 1);
#pragma unroll 4
        for (int tk = 0; tk < 32; ++tk) {
            float k[16], q[16];
#pragma unroll
            for (int i = 0; i < 4; ++i) { const v4f a = *(const LAS v4f*)(kb + cur * 4096 + tk * 128 + 16 * j + 4 * i); k[4 * i] = a.x; k[4 * i + 1] = a.y; k[4 * i + 2] = a.z; k[4 * i + 3] = a.w;
                                          const v4f b = *(const LAS v4f*)(qb + cur * 4096 + tk * 128 + 16 * j + 4 * i); q[4 * i] = b.x; q[4 * i + 1] = b.y; q[4 * i + 2] = b.z; q[4 * i + 3] = b.w; }
            const float v = vb[cur * 2048 + tk * 64 + el], eg = sb[cur * 64 + tk], be = sb[cur * 64 + 32 + tk];
            float ks = 0.f;
#pragma unroll
            for (int i = 0; i < 16; ++i) ks += k[i] * S[i];
            ks = sum8(ks);
            const float vn = be * (v - eg * ks);
            float o = 0.f;
#pragma unroll
            for (int i = 0; i < 16; ++i) { S[i] = eg * S[i] + k[i] * vn; o += q[i] * S[i]; }
            o = sum8(o);
            if (j == 0) GO[((size_t)c * 32 + tk) * BW + h * 128 + half * 64 + el] = o;
        }
        if (c + 1 < T / 32) lwrite(cur ^ 1);
        __syncthreads();
    }
}
__device__ __forceinline__ void mixer_mlstm_scan(const Params& p, int l, LAS unsigned char* lds, int h, int tid, int wave, int lane) {
    const int e = wave * 16 + (lane >> 2), j = lane & 3;
    const bf16* Z = (const bf16*)(p.ws + WS_Z); const float* SMALL = (const float*)(p.ws + WS_SMALL); float* HO = (float*)(p.ws + WS_HO);
    const float ib = p.in[I_MLIB][l * 4 + h], fb = p.in[I_MLFB][l * 4 + h];
    LAS float* qb = (LAS float*)lds;
    LAS float* kb = (LAS float*)(lds + 16384);
    LAS float* vb = (LAS float*)(lds + 32768);
    LAS float* sb = (LAS float*)(lds + 65536);
    float Cm[16], nv[16];
#pragma unroll
    for (int i = 0; i < 16; ++i) { Cm[i] = 0.f; nv[i] = 0.f; }
    v4u rqk, rv; float rs = 0.f;
    auto gload = [&](int c) { const size_t t0 = (size_t)c * 32;
        { const int tt = tid & 255, tk = tt >> 3, c8 = tt & 7; rqk = *(const v4u*)(Z + (t0 + tk) * ZC + (tid < 256 ? ZC_MLQ : ZC_MLK) + h * 64 + 8 * c8); }
        { const int tk = tid >> 4, c8 = tid & 15; rv = *(const v4u*)(Z + (t0 + tk) * ZC + ZC_MLV + h * 128 + 8 * c8); }
        if (tid < 32) rs = sigmoidf_(SMALL[(t0 + tid) * 16 + 12 + h] + fb); else if (tid < 64) rs = __expf(SMALL[(t0 + tid - 32) * 16 + 8 + h] + ib); };
    auto lwrite = [&](int b) { float f[8];
        unpack8(rqk, f); { const int tt = tid & 255; const float sc = tid < 256 ? 0.125f : 1.f; LAS float* dst = (tid < 256 ? qb : kb) + b * 2048 + 8 * tt;
            *(LAS v4f*)dst = (v4f){f[0] * sc, f[1] * sc, f[2] * sc, f[3] * sc}; *(LAS v4f*)(dst + 4) = (v4f){f[4] * sc, f[5] * sc, f[6] * sc, f[7] * sc}; }
        unpack8(rv, f); { LAS float* dst = vb + b * 4096 + 8 * tid; *(LAS v4f*)dst = (v4f){f[0], f[1], f[2], f[3]}; *(LAS v4f*)(dst + 4) = (v4f){f[4], f[5], f[6], f[7]}; }
        if (tid < 64) sb[b * 64 + tid] = rs; };
    gload(0); lwrite(0); __syncthreads();
    for (int c = 0; c < T / 32; ++c) {
        const int cur = c & 1;
        if (c + 1 < T / 32) gload(c + 1);
#pragma unroll 4
        for (int tk = 0; tk < 32; ++tk) {
            float k[16], q[16];
#pragma unroll
            for (int i = 0; i < 4; ++i) { const v4f a = *(const LAS v4f*)(kb + cur * 2048 + tk * 64 + 16 * j + 4 * i); k[4 * i] = a.x; k[4 * i + 1] = a.y; k[4 * i + 2] = a.z; k[4 * i + 3] = a.w;
                                          const v4f b = *(const LAS v4f*)(qb + cur * 2048 + tk * 64 + 16 * j + 4 * i); q[4 * i] = b.x; q[4 * i + 1] = b.y; q[4 * i + 2] = b.z; q[4 * i + 3] = b.w; }
            const float v = vb[cur * 4096 + tk * 128 + e], f = sb[cur * 64 + tk], ig = sb[cur * 64 + 32 + tk];
            const float iv = ig * v; float num = 0.f, den = 0.f;
#pragma unroll
            for (int i = 0; i < 16; ++i) { Cm[i] = f * Cm[i] + iv * k[i]; nv[i] = f * nv[i] + ig * k[i]; num += q[i] * Cm[i]; den += q[i] * nv[i]; }
            num = sum4(num); den = sum4(den);
            if (j == 0) HO[((size_t)c * 32 + tk) * BW + h * 128 + e] = num / fmaxf(fabsf(den), 1.f);
        }
        if (c + 1 < T / 32) lwrite(cur ^ 1);
        __syncthreads();
    }
}
__device__ __forceinline__ void mixer_gmlp_item(const Params& p, int l, LAS unsigned char* lds, int item, int tid, int wave, int lane) {
    const int chunk = item >> 2, g = item & 3; const size_t tok0 = (size_t)chunk * 128;
    const bf16* Z = (const bf16*)(p.ws + WS_Z); bf16* BR1 = (bf16*)(p.ws + WS_BR) + (size_t)1 * T * BW;
    const float* ng = p.in[I_GMNG] + l * BW; const float* nb = p.in[I_GMNB] + l * BW;
    const float* wsp = p.in[I_GMWS] + ((size_t)(l * 4 + g) * 128) * 128; const float* bsp = p.in[I_GMBS] + (l * 4 + g) * 128;
    LAS float* vn = (LAS float*)lds;
    for (int r = 0; r < 16; ++r) { const int tk = wave * 16 + r;
        const v4u raw = *(const v4u*)(Z + (tok0 + tk) * ZC + ZC_GMV + 8 * lane); float x[8]; unpack8(raw, x); float s = 0.f;
#pragma unroll
        for (int i = 0; i < 8; ++i) { x[i] = gelu_tanh(x[i]); s += x[i]; }
        const float mean = wave_sum(s) * (1.f / 512.f); float ss = 0.f;
#pragma unroll
        for (int i = 0; i < 8; ++i) { x[i] -= mean; ss += x[i] * x[i]; }
        const float rstd = rsqrtf(wave_sum(ss) * (1.f / 512.f) + LN_EPS);
        if ((lane >> 4) == g) { const int cl = 8 * (lane & 15);
#pragma unroll
            for (int i = 0; i < 8; ++i) vn[tk * 128 + cl + i] = x[i] * rstd * ng[8 * lane + i] + nb[8 * lane + i]; }
    }
    __syncthreads();
    const int t = tid >> 2, cq = tid & 3; float acc[32];
#pragma unroll
    for (int i = 0; i < 32; ++i) acc[i] = 0.f;
    const float* wrow = wsp + (size_t)t * 128;
    for (int s = 0; s <= t; ++s) { const float w = wrow[s]; const LAS float* row = vn + s * 128 + cq * 32;
#pragma unroll
        for (int i4 = 0; i4 < 8; ++i4) { const v4f a = *(const LAS v4f*)(row + 4 * i4); acc[4 * i4] += w * a.x; acc[4 * i4 + 1] += w * a.y; acc[4 * i4 + 2] += w * a.z; acc[4 * i4 + 3] += w * a.w; } }
    const float bias = bsp[t];
#pragma unroll
    for (int i8 = 0; i8 < 4; ++i8) { const v4u raw = *(const v4u*)(Z + (tok0 + t) * ZC + ZC_GMU + g * 128 + cq * 32 + 8 * i8); float u[8]; unpack8(raw, u); float o[8];
#pragma unroll
        for (int i = 0; i < 8; ++i) o[i] = gelu_tanh(u[i]) * (acc[8 * i8 + i] + bias);
        v4u w; w.x = pk2(o[0], o[1]); w.y = pk2(o[2], o[3]); w.z = pk2(o[4], o[5]); w.w = pk2(o[6], o[7]);
        *(v4u*)(BR1 + (tok0 + t) * BW + g * 128 + cq * 32 + 8 * i8) = w; }
    __syncthreads();
}
__device__ __forceinline__ void mixer_sb_item(const Params& p, LAS float* qs  , int item, int lane) {
    const int h = item >> 11, t0 = (item & 2047) * 4;
    const bf16* Z = (const bf16*)(p.ws + WS_Z); bf16* BR0 = (bf16*)(p.ws + WS_BR);
#pragma unroll
    for (int qi = 0; qi < 4; ++qi) { const unsigned w = *(const unsigned*)(Z + (size_t)(t0 + qi) * ZC + ZC_SBQ + h * 128 + 2 * lane);
        qs[qi * 128 + 2 * lane] = bflo(w) * 0.08838834764831845f; qs[qi * 128 + 2 * lane + 1] = bfhi(w) * 0.08838834764831845f; }
    LDS_WAIT(); asm volatile("" ::: "memory");
    float acc[4][2], racc[4];
#pragma unroll
    for (int qi = 0; qi < 4; ++qi) { acc[qi][0] = 0.f; acc[qi][1] = 0.f; racc[qi] = 0.f; }
    for (int base = t0 + 2; base >= 0; base -= 64) {
        const int s = base - lane; const bool vk = s >= 0; const int sc = vk ? s : 0;
        float z[4] = {0.f, 0.f, 0.f, 0.f};
        const bf16* krow = Z + (size_t)sc * ZC + ZC_SBK + h * 128;
#pragma unroll 4
        for (int c = 0; c < 16; ++c) { const v4u raw = *(const v4u*)(krow + 8 * c); float kf[8]; unpack8(raw, kf);
#pragma unroll
            for (int qi = 0; qi < 4; ++qi) { const v4f q0 = *(const LAS v4f*)(qs + qi * 128 + 8 * c), q1 = *(const LAS v4f*)(qs + qi * 128 + 8 * c + 4);
                z[qi] += q0.x * kf[0] + q0.y * kf[1] + q0.z * kf[2] + q0.w * kf[3] + q1.x * kf[4] + q1.y * kf[5] + q1.z * kf[6] + q1.w * kf[7]; } }
        float a[4];
#pragma unroll
        for (int qi = 0; qi < 4; ++qi) { const bool m = vk && (s < t0 + qi); const float sp = m ? softplusf_(z[qi]) : 0.f;
            const float incl = wave_scan_incl(sp); const float tot = __builtin_bit_cast(float, __builtin_amdgcn_readlane(__builtin_bit_cast(int, incl), 63));
            a[qi] = m ? __expf(z[qi] - sp - (racc[qi] + (incl - sp))) : 0.f; racc[qi] += tot; }
#pragma unroll 8
        for (int kl = 0; kl < 64; ++kl) { int sk = base - kl; sk = sk < 0 ? 0 : sk;
            const unsigned w = *(const unsigned*)(Z + (size_t)sk * ZC + ZC_SBV + h * 128 + 2 * lane); const float v0 = bflo(w), v1 = bfhi(w);
#pragma unroll
            for (int qi = 0; qi < 4; ++qi) { const float aw = __builtin_bit_cast(float, __builtin_amdgcn_readlane(__builtin_bit_cast(int, a[qi]), kl)); acc[qi][0] += aw * v0; acc[qi][1] += aw * v1; } }
        if (fminf(fminf(racc[0], racc[1]), fminf(racc[2], racc[3])) > 104.f) break;
    }
#pragma unroll
    for (int qi = 0; qi < 4; ++qi) *(unsigned*)(BR0 + (size_t)(t0 + qi) * BW + h * 128 + 2 * lane) = pk2(acc[qi][0], acc[qi][1]);
}
__device__ __forceinline__ void phase_mixers(const Params& p, int l, LAS unsigned char* lds, int wg, int G, int tid, int wave, int lane) {
    if (wg < 8) { mixer_gdn_scan(p, lds, wg, tid, wave, lane); return; }
    if (wg < 12) { mixer_mlstm_scan(p, l, lds, wg - 8, tid, wave, lane); return; }
    const int w2 = wg - 12, G2 = G - 12;
    for (int it = w2; it < 256; it += G2) mixer_gmlp_item(p, l, lds, it, tid, wave, lane);
    LAS float* qs = (LAS float*)(lds + wave * 2048);
    for (int it = w2 * 8 + wave; it < 4 * 2048; it += G2 * 8) mixer_sb_item(p, qs, it, lane);
}

__device__ __forceinline__ void phase_post(const Params& p, int l, int gw, int NGW, int lane) {
    const bf16* Z = (const bf16*)(p.ws + WS_Z); const float* GO = (const float*)(p.ws + WS_GO); const float* HO = (const float*)(p.ws + WS_HO);
    bf16* BR2 = (bf16*)(p.ws + WS_BR) + (size_t)2 * T * BW; bf16* BR3 = (bf16*)(p.ws + WS_BR) + (size_t)3 * T * BW;
    const float* gng = p.in[I_GDNNG] + l * 128; const float* mng = p.in[I_MLNG] + l * BW;
    for (int t = gw; t < T; t += NGW) {
        {   const v4f a0 = *(const v4f*)(GO + (size_t)t * BW + 8 * lane), a1 = *(const v4f*)(GO + (size_t)t * BW + 8 * lane + 4); float o[8] = {a0.x, a0.y, a0.z, a0.w, a1.x, a1.y, a1.z, a1.w}; float ss = 0.f;
#pragma unroll
            for (int i = 0; i < 8; ++i) ss += o[i] * o[i];
            const float r = rsqrtf(sum16(ss) * (1.f / 128.f) + LN_EPS);
            const v4u graw = *(const v4u*)(Z + (size_t)t * ZC + ZC_GDNG + 8 * lane); float gt[8]; unpack8(graw, gt);
#pragma unroll
            for (int i = 0; i < 8; ++i) o[i] = o[i] * r * gng[(8 * lane + i) & 127] * siluf_(gt[i]);
            v4u w; w.x = pk2(o[0], o[1]); w.y = pk2(o[2], o[3]); w.z = pk2(o[4], o[5]); w.w = pk2(o[6], o[7]); *(v4u*)(BR2 + (size_t)t * BW + 8 * lane) = w; }
        {   const v4f a0 = *(const v4f*)(HO + (size_t)t * BW + 8 * lane), a1 = *(const v4f*)(HO + (size_t)t * BW + 8 * lane + 4); float o[8] = {a0.x, a0.y, a0.z, a0.w, a1.x, a1.y, a1.z, a1.w}; float ss = 0.f;
#pragma unroll
            for (int i = 0; i < 8; ++i) ss += o[i] * o[i];
            const float r = rsqrtf(sum16(ss) * (1.f / 128.f) + LN_EPS);
            const v4u graw = *(const v4u*)(Z + (size_t)t * ZC + ZC_MLO + 8 * lane); float gt[8]; unpack8(graw, gt);
#pragma unroll
            for (int i = 0; i < 8; ++i) o[i] = o[i] * r * mng[8 * lane + i] * sigmoidf_(gt[i]);
            v4u w; w.x = pk2(o[0], o[1]); w.y = pk2(o[2], o[3]); w.z = pk2(o[4], o[5]); w.w = pk2(o[6], o[7]); *(v4u*)(BR3 + (size_t)t * BW + 8 * lane) = w; }
    }
}

__device__ __forceinline__ void ln_row(const float* yrow, const float* g, const float* b, int lane, v4f (&v)[8]) {
    const v4f* yr = (const v4f*)yrow + lane; float s = 0.f;
#pragma unroll
    for (int j = 0; j < 8; ++j) { v[j] = yr[64 * j]; s += (v[j].x + v[j].y) + (v[j].z + v[j].w); }
    const float mean = wave_sum(s) * (1.f / D); float s2 = 0.f;
#pragma unroll
    for (int j = 0; j < 8; ++j) { v[j] = v[j] - mean; s2 += (v[j].x * v[j].x + v[j].y * v[j].y) + (v[j].z * v[j].z + v[j].w * v[j].w); }
    const float rstd = rsqrtf(wave_sum(s2) * (1.f / D) + LN_EPS);
#pragma unroll
    for (int j = 0; j < 8; ++j) { const v4f gg = ((const v4f*)g)[lane + 64 * j], bb = ((const v4f*)b)[lane + 64 * j]; v[j] = v[j] * rstd * gg + bb; }
}
__device__ __forceinline__ void phase_ln1_router(const Params& p, int l, LAS unsigned char* lds, int wg, int G, int wave, int lane) {
    const float* Y = (const float*)(p.ws + WS_Y); float* X1 = (float*)(p.ws + WS_X1); bf16* X1B = (bf16*)(p.ws + WS_X1B); int* LIST = (int*)(p.ws + WS_LIST); float* WL = (float*)(p.ws + WS_WL); unsigned* SLOT = (unsigned*)(p.ws + WS_SLOT);
    unsigned* cnt = (unsigned*)(p.ws + WS_CTL) + CW_CNT + l * 4096;
    const float* g1 = p.in[I_LN1G] + (size_t)l * D; const float* b1 = p.in[I_LN1B] + (size_t)l * D;
    const float* wr = p.in[I_WR] + (size_t)l * D * NE; const float rbias = p.in[I_RB][l * NE + lane];
    LAS float* xt = (LAS float*)lds;
    LAS float* part = (LAS float*)(lds + 65536);
    for (int tl = wg; tl < T / 8; tl += G) {
        const size_t m = (size_t)tl * 8 + wave;
        {   v4f v[8]; ln_row(Y + m * D, g1, b1, lane, v);
            v4f* xo = (v4f*)(X1 + m * D) + lane; v2u* xb = (v2u*)(X1B + m * D) + lane;
#pragma unroll
            for (int j = 0; j < 8; ++j) { xo[64 * j] = v[j]; v2u o; o.x = pk2(v[j].x, v[j].y); o.y = pk2(v[j].z, v[j].w); xb[64 * j] = o; *(LAS v4f*)(xt + wave * D + 4 * lane + 256 * j) = v[j]; } }
        __syncthreads();
        {   float acc[8];
#pragma unroll
            for (int r = 0; r < 8; ++r) acc[r] = 0.f;
#pragma unroll 2
            for (int d4 = 0; d4 < 64; ++d4) { const int d = wave * 256 + 4 * d4;
                const float w0 = wr[(size_t)(d + 0) * NE + lane], w1 = wr[(size_t)(d + 1) * NE + lane], w2 = wr[(size_t)(d + 2) * NE + lane], w3 = wr[(size_t)(d + 3) * NE + lane];
#pragma unroll
                for (int r = 0; r < 8; ++r) { const v4f xv = *(const LAS v4f*)(xt + r * D + d); acc[r] += xv.x * w0 + xv.y * w1 + xv.z * w2 + xv.w * w3; } }
#pragma unroll
            for (int r = 0; r < 8; ++r) part[(wave * 8 + r) * 64 + lane] = acc[r]; }
        __syncthreads();
        {   float logit = 0.f;
#pragma unroll
            for (int w = 0; w < 8; ++w) logit += part[(w * 8 + wave) * 64 + lane];
            const float s = sigmoidf_(logit), biased = s + rbias;
            const float m1 = max8(biased); const float li = (float)(lane & 7);
            const float first = min8(biased == m1 ? li : 8.f);
            const float m2 = max8(li == first ? -INFINITY : biased);
            const float gs = m1 + m2; const int myg = lane >> 3; int grank = 0;
#pragma unroll
            for (int g2 = 0; g2 < 8; ++g2) { const float o = __builtin_bit_cast(float, __builtin_amdgcn_readlane(__builtin_bit_cast(int, gs), g2 * 8)); grank += (o > gs || (o == gs && g2 < myg)) ? 1 : 0; }
            const float masked = grank < 4 ? biased : -INFINITY; int rank = 0;
#pragma unroll
            for (int e2 = 0; e2 < 64; ++e2) { const float o = __builtin_bit_cast(float, __builtin_amdgcn_readlane(__builtin_bit_cast(int, masked), e2)); rank += (o > masked || (o == masked && e2 < lane)) ? 1 : 0; }
            const float wsel = rank < 6 ? s : 0.f; const float tot = wave_sum(wsel);
            if (rank < 6) { const unsigned pos = __hip_atomic_fetch_add(cnt + 64 * lane, 1u, __ATOMIC_RELAXED, __HIP_MEMORY_SCOPE_AGENT);
                LIST[lane * T + pos] = (int)m; WL[lane * T + pos] = wsel / tot * 2.5f; SLOT[m * 8 + rank] = ((unsigned)lane << 16) | pos; } }
        __syncthreads();
    }
}
__device__ __forceinline__ void phase_combine_ln2(const Params& p, int l, float* dst, int gw, int NGW, int lane) {
    const float* X1 = (const float*)(p.ws + WS_X1); const bf16* YE = (const bf16*)(p.ws + WS_YEXP); const unsigned* SLOT = (const unsigned*)(p.ws + WS_SLOT);
    const unsigned* cnt = (const unsigned*)(p.ws + WS_CTL) + CW_CNT + l * 4096;
    const float* g2 = p.in[I_LN2G] + (size_t)l * D; const float* b2 = p.in[I_LN2B] + (size_t)l * D;
    const int tiles = ((int)cnt[64 * lane] + 255) >> 8; const float incl = wave_scan_incl((float)tiles);
    const int toff = (int)incl - tiles;
    const int tsh = __builtin_amdgcn_readlane((int)incl, 63);
    for (int m = gw; m < T; m += NGW) {
        v4f v[8]; const v4f* xr = (const v4f*)(X1 + (size_t)m * D) + lane;
#pragma unroll
        for (int j = 0; j < 8; ++j) v[j] = xr[64 * j] * ALPHA;
#pragma unroll
        for (int k = 0; k < 7; ++k) { size_t row;
            if (k == 0) row = (size_t)tsh * 256 + m;
            else { const unsigned s = __builtin_amdgcn_readfirstlane(SLOT[(size_t)m * 8 + (k - 1)]); const int e = (int)(s >> 16); row = (size_t)__builtin_amdgcn_readlane(toff, e) * 256 + (s & 0xffffu); }
            const v2u* yr = (const v2u*)(YE + row * D) + lane;
#pragma unroll
            for (int j = 0; j < 8; ++j) { const v2u y = yr[64 * j]; v[j].x += bflo(y.x); v[j].y += bfhi(y.x); v[j].z += bflo(y.y); v[j].w += bfhi(y.y); } }
        float s = 0.f;
#pragma unroll
        for (int j = 0; j < 8; ++j) s += (v[j].x + v[j].y) + (v[j].z + v[j].w);
        const float mean = wave_sum(s) * (1.f / D); float s2 = 0.f;
#pragma unroll
        for (int j = 0; j < 8; ++j) { v[j] = v[j] - mean; s2 += (v[j].x * v[j].x + v[j].y * v[j].y) + (v[j].z * v[j].z + v[j].w * v[j].w); }
        const float rstd = rsqrtf(wave_sum(s2) * (1.f / D) + LN_EPS);
        v4f* xo = (v4f*)(dst + (size_t)m * D) + lane;
#pragma unroll
        for (int j = 0; j < 8; ++j) { const v4f gg = ((const v4f*)g2)[lane + 64 * j], bb = ((const v4f*)b2)[lane + 64 * j]; xo[64 * j] = v[j] * rstd * gg + bb; }
    }
}

constexpr int NPH = 11;
template <int l>
__device__ __forceinline__ void run_layer(const Params& p, LAS unsigned char* lds, const XcdBarrier& bar, int tid, int lane, int wave, int G, int wg, int gw, int NGW) {
    unsigned char* ws = p.ws;
    {
        const float* xin = (l == 0) ? p.in[I_X] : (const float*)(ws + WS_XCUR);
        float* xout = (l == NL - 1) ? p.out : (float*)(ws + WS_XCUR);
#ifndef PH_MASK
#define PH_MASK 0x7ff
#endif
#define RUN(k) (((PH_MASK >> (k)) & 1) && p.ph_lo <= l * NPH + (k) && l * NPH + (k) < p.ph_hi)
#define SEAM(k) do { if (l * NPH + (k) + 1 < p.ph_hi) xcd_barrier(bar); } while (0)
        if (RUN(0)) { phase_convert(p, l, lds, gw, NGW, wave, lane); phase_xprep(p, l, xin, lds, gw, NGW, tid, lane); SEAM(0); }
        if (RUN(1)) { pg8::Gemm g{(const bf16*)(ws + WS_XB), (const bf16*)(ws + WS_WIN), T, ZC, D, D, D}; pg8::StaticOrder S; S.init(T, ZC, G, wg);
            pg8::EpiBf16<0> E{(bf16*)(ws + WS_Z), ZC, nullptr, 0, 0, 1.f};
            pg8::gemm_phase<pg8::EpiBf16<0>, pg8::StaticOrder, true, true>(lds, g, S, E); SEAM(1); }
        if (RUN(2)) { phase_gdn_prep(p, l, gw, NGW, lane); SEAM(2); }
        if (RUN(3)) { phase_mixers(p, l, lds, wg, G, tid, wave, lane); SEAM(3); }
        if (RUN(4)) { phase_post(p, l, gw, NGW, lane); SEAM(4); }
        if (RUN(5)) { pg8::Gemm g{(const bf16*)(ws + WS_BR), (const bf16*)(ws + WS_WBR), 4 * T, 4 * D, BW, BW, BW}; MergeOrder S{G, wg};
            EpiMerge E{(const bf16*)(ws + WS_Z), (float*)(ws + WS_MTMP), (bf16*)(ws + WS_MSUM)};
            pg8::gemm_phase<EpiMerge, MergeOrder, true, true>(lds, g, S, E); SEAM(5); }
        if (RUN(6)) { pg8::Gemm g{(const bf16*)(ws + WS_MSUM), (const bf16*)(ws + WS_WOUT), T, D, D, D, D}; pg8::StaticOrder S; S.init(T, D, G, wg);
            EpiResid E{xin, (float*)(ws + WS_Y)};
            pg8::gemm_phase<EpiResid, pg8::StaticOrder, true, true>(lds, g, S, E); SEAM(6); }
        if (RUN(7)) { phase_ln1_router(p, l, lds, wg, G, wave, lane); SEAM(7); }
        if (RUN(8)) { const unsigned* cnt = (const unsigned*)(ws + WS_CTL) + CW_CNT + l * 4096; MoeTab M(lds); moe_tables(M, cnt, tid, lane, wave);
            UpOrder S{M, 0}; S.n = up_order_build(M, (const int*)(ws + WS_LIST), (const float*)(ws + WS_WL), wg, G, tid);
            pg8::Gemm g{(const bf16*)(ws + WS_X1B), (const bf16*)(ws + WS_WUP), T, NEX * 1024, D, D, D};
            EpiGluSparse E{(LAS const float*)M.wt, (bf16*)(ws + WS_HB)};
            pg8::gemm_phase_gather<EpiGluSparse, UpOrder>(lds, g, S, E); SEAM(8); }
        if (RUN(9)) { const unsigned* cnt = (const unsigned*)(ws + WS_CTL) + CW_CNT + l * 4096; MoeTab M(lds); moe_tables(M, cnt, tid, lane, wave);
            DownOrder S{M, G, wg, 8 * M.t[65]};
            pg8::Gemm g{(const bf16*)(ws + WS_HB), (const bf16*)(ws + WS_WDN), HROWS, NEX * D, ED, ED, ED};
            EpiYexp E{(bf16*)(ws + WS_YEXP)};
            pg8::gemm_phase<EpiYexp, DownOrder, true, true>(lds, g, S, E); SEAM(9); }
        if (RUN(10)) { phase_combine_ln2(p, l, xout, gw, NGW, lane); SEAM(10); }
#undef RUN
#undef SEAM
    }
}
__global__ void __launch_bounds__(512, 2) fwd_kernel(Params p) {
    extern __shared__ __attribute__((aligned(16))) unsigned char lds_raw[];
    LAS unsigned char* lds = (LAS unsigned char*)lds_raw;
    const int tid = threadIdx.x, lane = tid & 63, wave = __builtin_amdgcn_readfirstlane(tid >> 6);
    const int G = gridDim.x, wg = blockIdx.x, gw = wg * 8 + wave, NGW = G * 8;
    volatile LAS unsigned* MISC = (volatile LAS unsigned*)(lds + MISC_OFF);
    if (tid < 32) MISC[tid] = 0u;
    __syncthreads();
    unsigned* ctl = (unsigned*)(p.ws + WS_CTL);
    const bool multi = (p.ph_hi - p.ph_lo) > 1;
    XcdBarrier bar; bar.bar = ctl + CW_BAR; bar.x = 0; bar.st = nullptr;
    if (multi) bar = xcd_barrier_post(ctl + CW_BAR, MISC + 8);
    run_layer<0>(p, lds, bar, tid, lane, wave, G, wg, gw, NGW);
    run_layer<1>(p, lds, bar, tid, lane, wave, G, wg, gw, NGW);
}

#ifndef MK_MULTI_LAUNCH
#define MK_MULTI_LAUNCH 0
#endif
extern "C" void kernel_launch(void* const* d_in, const int* in_sizes, int n_in, void* d_out, int out_size, void* d_ws, size_t ws_size, hipStream_t stream) {
    static int grid = 0;
    if (grid == 0) {
        if (n_in != 27 || out_size != T * D || ws_size < WS_END) { fprintf(stderr, "kernel_launch: unexpected shapes (n_in %d out %d ws %zu need %zu)\n", n_in, out_size, ws_size, (size_t)WS_END); grid = -1; return; }
        int dev = 0, cus = 0, per_cu = 0;
        if (hipGetDevice(&dev) != hipSuccess || hipDeviceGetAttribute(&cus, hipDeviceAttributeMultiprocessorCount, dev) != hipSuccess) { grid = -1; return; }
        if (hipFuncSetAttribute((const void*)fwd_kernel, hipFuncAttributeMaxDynamicSharedMemorySize, LDS_BYTES) != hipSuccess) { fprintf(stderr, "kernel_launch: hipFuncSetAttribute failed\n"); grid = -1; return; }
        if (hipOccupancyMaxActiveBlocksPerMultiprocessor(&per_cu, (const void*)fwd_kernel, 512, LDS_BYTES) != hipSuccess || per_cu < 1) { fprintf(stderr, "kernel_launch: occupancy query says %d\n", per_cu); }
        (void)hipGetLastError();
        grid = cus;
    }
    if (grid < 0) return;
    (void)hipMemsetAsync((char*)d_ws + WS_CTL, 0, CTL_ZERO_BYTES, stream);
    Params p{};
    for (int i = 0; i < 27; ++i) p.in[i] = (const float*)d_in[i];
    p.out = (float*)d_out; p.ws = (unsigned char*)d_ws;
#if MK_MULTI_LAUNCH
    for (int ph = 0; ph < NL * NPH; ++ph) { p.ph_lo = ph; p.ph_hi = ph + 1; hipLaunchKernelGGL(fwd_kernel, dim3(grid), dim3(512), LDS_BYTES, stream, p); }
#else
    p.ph_lo = 0; p.ph_hi = NL * NPH; hipLaunchKernelGGL(fwd_kernel, dim3(grid), dim3(512), LDS_BYTES, stream, p);
#endif
}
```

```cpp
#include <hip/hip_runtime.h>
#include <cstdio>
#include <cstdint>
namespace pg8 {
#define PG8_LAS __attribute__((address_space(3)))
typedef unsigned short bf16_t;
typedef short bf16x8 __attribute__((ext_vector_type(8)));
typedef float f32x4 __attribute__((ext_vector_type(4)));
typedef unsigned u32x4 __attribute__((ext_vector_type(4)));
constexpr int BM = 256, BK = 64, HALF = 128, HTB = HALF * BK * 2  , STAGE_BYTES = 8 * HTB, NXCD = 8, WGM = 8;

__host__ __device__ __forceinline__ int lds_byte(int r, int c) { const int st = (r >> 4) * 2 + (c >> 5), rr = r & 15, cc = c & 31, ob = rr * 64 + cc * 2; return st * 1024 + (ob ^ (((ob >> 9) & 1) << 5)); }
__host__ __device__ __forceinline__ void stage_rc(int b, int& R, int& C) { const int st = b / 1024, sb = b % 1024, swz = sb ^ (((sb >> 9) & 1) << 5); R = (st >> 1) * 16 + swz / 64; C = (st & 1) * 32 + (swz % 64) / 2; }
__host__ __device__ __forceinline__ int perm32(int rho) { const int n = rho >> 4, i = rho & 15; return 8 * (i >> 2) + 4 * n + (i & 3); }

struct Unit { int pm, pn, aux; };
struct Gemm { const bf16_t* A; const bf16_t* Bt; int M, N, K, lda, ldb; };

struct StaticOrder {
    int nM, nN, nwg, G, c;
    __host__ __device__ void init(int M, int N, int G_, int c_) { nM = M / BM; nN = N / BM; nwg = nM * nN; G = G_; c = c_; }
    __host__ __device__ bool next(int i, Unit& u) const {
        const long L = (long)i * G + c; if (L >= nwg) return false;
        int wgid = (int)L; { const int q = nwg / NXCD, r = nwg % NXCD, xcd = wgid % NXCD, off = wgid / NXCD; wgid = (xcd < r ? xcd * (q + 1) : r * (q + 1) + (xcd - r) * q) + off; }
        const int nig = WGM * nN, gid = wgid / nig, fm = gid * WGM, gsz = (nM - fm) < WGM ? (nM - fm) : WGM;
        u.pm = fm + ((wgid % nig) % gsz); u.pn = (wgid % nig) / gsz; return true;
    }
    __device__ __forceinline__ void a_ready(const Unit&) const {}
    __device__ __forceinline__ void done(const Unit&) const {}
};

__device__ __forceinline__ unsigned cvt_pk_bf16(float lo, float hi) { unsigned r; asm volatile("v_cvt_pk_bf16_f32 %0, %1, %2" : "=v"(r) : "v"(lo), "v"(hi)); return r; }
typedef float f32x2 __attribute__((ext_vector_type(2)));
__device__ __forceinline__ f32x2 gelu_pk(f32x2 v) {
    const f32x2 av = __builtin_elementwise_abs(v), d = av * 0.2316418882f + 1.0f;
    f32x2 t; t.x = __builtin_amdgcn_rcpf(d.x); t.y = __builtin_amdgcn_rcpf(d.y);
    f32x2 q = t * 0.5307027145f + (-0.7265760135f); q = q * t + 0.7107068705f; q = q * t + (-0.142248368f); q = q * t + 0.127414796f; q = q * t;
    const f32x2 s = (v * v) * (-0.72134752044f);
    f32x2 e; e.x = __builtin_amdgcn_exp2f(s.x); e.y = __builtin_amdgcn_exp2f(s.y);
    const f32x2 m = v * (q * e), r = v - m;
    f32x2 o; o.x = v.x < 0.f ? m.x : r.x; o.y = v.y < 0.f ? m.y : r.y; return o;
}

template <int ACT  > struct EpiBf16 {
    static constexpr bool PERM = true, AFTER_DRAIN = false; static_assert(ACT == 0 || ACT == 1, "EpiBf16: ACT is 0 (none) or 1 (gelu_pk)");
    bf16_t* O; int ldc; const float* bias; int split_cols; size_t split_stride; float scale0;
    __device__ __forceinline__ void operator()(const f32x4 (&acc)[2][2][4][2], const Unit& u, int wr, int wc, int fr, int fq) const {
        const int row0 = u.pm * BM + wr * 64 + fr; int colt = u.pn * BM; bf16_t* base = O;
        float sc = 1.f; if (split_cols) { const int t = colt / split_cols; base += (size_t)t * split_stride; colt -= t * split_cols; if (t == 0) sc = scale0; }
        const int col0 = colt + wc * 32 + 8 * fq, bcol0 = u.pn * BM + wc * 32 + 8 * fq;
        f32x4 bv[2][2];
#pragma unroll
        for (int bj = 0; bj < 2; ++bj)
#pragma unroll
            for (int n = 0; n < 2; ++n) bv[bj][n] = bias ? *(const f32x4*)(bias + bcol0 + bj * HALF + 4 * n) : (f32x4){0.f, 0.f, 0.f, 0.f};
#pragma unroll
        for (int ai = 0; ai < 2; ++ai)
#pragma unroll
            for (int m = 0; m < 4; ++m) { bf16_t* rowp = base + (size_t)(row0 + ai * HALF + m * 16) * ldc + col0;
#pragma unroll
                for (int bj = 0; bj < 2; ++bj) { f32x4 v0 = acc[ai][bj][m][0] + bv[bj][0], v1 = acc[ai][bj][m][1] + bv[bj][1];
                    if (ACT == 1) { f32x2 a = gelu_pk((f32x2){v0[0], v0[1]}), b = gelu_pk((f32x2){v0[2], v0[3]}), c = gelu_pk((f32x2){v1[0], v1[1]}), d = gelu_pk((f32x2){v1[2], v1[3]});
                        v0 = (f32x4){a.x, a.y, b.x, b.y}; v1 = (f32x4){c.x, c.y, d.x, d.y}; }
                    v0 = v0 * sc; v1 = v1 * sc; u32x4 w; w.x = cvt_pk_bf16(v0[0], v0[1]); w.y = cvt_pk_bf16(v0[2], v0[3]); w.z = cvt_pk_bf16(v1[0], v1[1]); w.w = cvt_pk_bf16(v1[2], v1[3]);
                    *(u32x4*)(rowp + bj * HALF) = w; } }
    }
};

template <class Epi, class Sched, bool ALIGN_EPI = false, bool SP2 = false>
__device__ __forceinline__ void gemm_phase(PG8_LAS unsigned char* lds, const Gemm g, const Sched& S, const Epi& E) {
    const int tid = threadIdx.x, wid = __builtin_amdgcn_readfirstlane(tid >> 6), lane = tid & 63, wr = wid >> 2, wc = wid & 3, fr = lane & 15, fq = lane >> 4;
    const int K = g.K, nt = K / BK;
    unsigned voffA[2], voffB[2];
#pragma unroll
    for (int i = 0; i < 2; ++i) { int R, C; stage_rc(tid * 16 + i * 8192, R, C); const int Rb = Epi::PERM ? ((R & ~31) + perm32(R & 31)) : R;
        voffA[i] = (unsigned)(R * g.lda + C) * 2u; voffB[i] = (unsigned)(Rb * g.ldb + C) * 2u; }
    const size_t kstep = (size_t)(BK * 2);
    const size_t hstepA = (size_t)HALF * g.lda * 2, hstepB = (size_t)HALF * g.ldb * 2;
    const size_t tstepA = 2 * hstepA, tstepB = 2 * hstepB;
    const unsigned ldsw = (unsigned)wid * 1024u;
    const int aoff = lds_byte(wr * 64 + fr, fq * 8), boff = lds_byte(wc * 32 + fr, fq * 8);
#define PG8_SA(b, h) (((b) * 2 + (h)) * HTB)
#define PG8_SB(b, h) ((4 + (b) * 2 + (h)) * HTB)
#define PG8_STAGE(bufoff, gbase, voff) do { _Pragma("unroll") for (int _i = 0; _i < 2; ++_i) \
        __builtin_amdgcn_global_load_lds((const unsigned*)((const char*)(gbase) + (voff)[_i]), (PG8_LAS unsigned*)(lds + (bufoff) + ldsw + _i * 8192), 16, 0, 0); } while (0)
#define PG8_LDA(dst, b, h) do { _Pragma("unroll") for (int m = 0; m < 4; ++m) _Pragma("unroll") for (int k = 0; k < 2; ++k) dst[m][k] = *(const PG8_LAS bf16x8*)(lds + PG8_SA(b, h) + aoff + m * 2048 + k * 1024); } while (0)
#define PG8_LDB(dst, b, h) do { _Pragma("unroll") for (int n = 0; n < 2; ++n) _Pragma("unroll") for (int k = 0; k < 2; ++k) dst[n][k] = *(const PG8_LAS bf16x8*)(lds + PG8_SB(b, h) + boff + n * 2048 + k * 1024); } while (0)
#define PG8_MMA(ai, bj, At, Bt) do { __builtin_amdgcn_s_setprio(1); _Pragma("unroll") for (int m = 0; m < 4; ++m) _Pragma("unroll") for (int n = 0; n < 2; ++n) _Pragma("unroll") for (int k = 0; k < 2; ++k) \
        acc[ai][bj][m][n] = __builtin_amdgcn_mfma_f32_16x16x32_bf16(Bt[n][k], At[m][k], acc[ai][bj][m][n], 0, 0, 0); __builtin_amdgcn_s_setprio(0); } while (0)
#define PG8_WAIT_V(n) asm volatile("s_waitcnt vmcnt(" #n ")" ::: "memory")
#define PG8_WAIT_L(n) asm volatile("s_waitcnt lgkmcnt(" #n ")" ::: "memory")
#define PG8_BAR __builtin_amdgcn_s_barrier()
#define PG8_SCHED __builtin_amdgcn_sched_barrier(0)
    Unit cur, nxt; int ui = 0;
    if (!S.next(0, cur)) return;
    f32x4 acc[2][2][4][2];
#pragma unroll
    for (int a = 0; a < 2; ++a)
#pragma unroll
        for (int b = 0; b < 2; ++b)
#pragma unroll
            for (int m = 0; m < 4; ++m)
#pragma unroll
                for (int n = 0; n < 2; ++n) acc[a][b][m][n] = (f32x4){0.f, 0.f, 0.f, 0.f};
    bf16x8 At[4][2], B0[2][2], B1[2][2];
    const char* cA = (const char*)g.A + (size_t)cur.pm * tstepA; const char* cB = (const char*)g.Bt + (size_t)cur.pn * tstepB;
    S.a_ready(cur);
    if constexpr (SP2) {
        PG8_STAGE(PG8_SB(0, 0), cB, voffB); PG8_STAGE(PG8_SB(0, 1), cB + hstepB, voffB); PG8_STAGE(PG8_SA(0, 0), cA, voffA); PG8_STAGE(PG8_SA(0, 1), cA + hstepA, voffA);
        if (wr == 1) PG8_BAR;
        PG8_WAIT_V(2); PG8_BAR;
        PG8_STAGE(PG8_SB(1, 0), cB + kstep, voffB); PG8_STAGE(PG8_SA(1, 0), cA + kstep, voffA); PG8_STAGE(PG8_SB(1, 1), cB + hstepB + kstep, voffB);
        PG8_WAIT_V(6); PG8_BAR;
    } else {
        PG8_STAGE(PG8_SB(0, 0), cB, voffB); PG8_STAGE(PG8_SA(0, 0), cA, voffA); PG8_STAGE(PG8_SB(0, 1), cB + hstepB, voffB); PG8_STAGE(PG8_SA(0, 1), cA + hstepA, voffA);
        if (wr == 1) PG8_BAR;
        PG8_WAIT_V(4); PG8_BAR;
        PG8_STAGE(PG8_SB(1, 0), cB + kstep, voffB); PG8_STAGE(PG8_SA(1, 0), cA + kstep, voffA); PG8_STAGE(PG8_SB(1, 1), cB + hstepB + kstep, voffB);
        PG8_WAIT_V(6); PG8_BAR;
    }
    for (;;) {
        const bool has_next = S.next(ui + 1, nxt);
        const char* nA = has_next ? (const char*)g.A + (size_t)nxt.pm * tstepA : cA; const char* nB = has_next ? (const char*)g.Bt + (size_t)nxt.pn * tstepB : cB;
        for (int t = 0; t < nt; t += 2) {
            const bool last = (t == nt - 2);
            const char* a1 = cA + (size_t)(t + 1) * kstep;
            const char* a2 = last ? nA : cA + (size_t)(t + 2) * kstep; const char* b2 = last ? nB : cB + (size_t)(t + 2) * kstep;
            const char* a3 = a2 + kstep; const char* b3 = b2 + kstep;
            if (last && has_next) S.a_ready(nxt);
            if constexpr (SP2) {
            PG8_LDB(B0, 0, 0); PG8_LDB(B1, 0, 1); PG8_SCHED; PG8_LDA(At, 0, 0); PG8_STAGE(PG8_SA(1, 1), a1 + hstepA, voffA);
            PG8_WAIT_V(8); PG8_WAIT_L(0); PG8_BAR; PG8_MMA(0, 0, At, B0); PG8_MMA(0, 1, At, B1); PG8_BAR; PG8_SCHED;
            PG8_LDA(At, 0, 1); PG8_STAGE(PG8_SB(0, 0), b2, voffB); PG8_STAGE(PG8_SB(0, 1), b2 + hstepB, voffB); PG8_STAGE(PG8_SA(0, 0), a2, voffA);
            PG8_WAIT_V(8); PG8_WAIT_L(0); PG8_BAR; PG8_MMA(1, 0, At, B0); PG8_MMA(1, 1, At, B1); PG8_BAR; PG8_SCHED;
            PG8_LDB(B0, 1, 0); PG8_LDB(B1, 1, 1); PG8_SCHED; PG8_LDA(At, 1, 0); PG8_STAGE(PG8_SA(0, 1), a2 + hstepA, voffA);
            PG8_WAIT_V(8); PG8_WAIT_L(0); PG8_BAR; PG8_MMA(0, 0, At, B0); PG8_MMA(0, 1, At, B1); PG8_BAR; PG8_SCHED;
            PG8_LDA(At, 1, 1); PG8_STAGE(PG8_SB(1, 0), b3, voffB); PG8_STAGE(PG8_SB(1, 1), b3 + hstepB, voffB); PG8_STAGE(PG8_SA(1, 0), a3, voffA);
            PG8_WAIT_V(8); PG8_WAIT_L(0); PG8_BAR; PG8_MMA(1, 0, At, B0); PG8_MMA(1, 1, At, B1); PG8_BAR; PG8_SCHED;
            } else {
            PG8_LDB(B0, 0, 0); PG8_SCHED; PG8_LDA(At, 0, 0); PG8_STAGE(PG8_SA(1, 1), a1 + hstepA, voffA);
            PG8_WAIT_L(8); PG8_BAR; PG8_WAIT_L(0); PG8_MMA(0, 0, At, B0); PG8_BAR; PG8_SCHED;
            PG8_LDB(B1, 0, 1); PG8_STAGE(PG8_SB(0, 0), b2, voffB);
            PG8_BAR; PG8_WAIT_L(0); PG8_MMA(0, 1, At, B1); PG8_BAR;
            PG8_LDA(At, 0, 1); PG8_STAGE(PG8_SA(0, 0), a2, voffA);
            PG8_BAR; PG8_WAIT_L(0); PG8_MMA(1, 0, At, B0); PG8_BAR; PG8_SCHED;
            PG8_STAGE(PG8_SB(0, 1), b2 + hstepB, voffB);
            PG8_WAIT_V(6); PG8_BAR; PG8_MMA(1, 1, At, B1); PG8_BAR;
            PG8_LDB(B0, 1, 0); PG8_SCHED; PG8_LDA(At, 1, 0); PG8_STAGE(PG8_SA(0, 1), a2 + hstepA, voffA);
            PG8_WAIT_L(8); PG8_BAR; PG8_WAIT_L(0); PG8_MMA(0, 0, At, B0); PG8_BAR; PG8_SCHED;
            PG8_LDB(B1, 1, 1); PG8_STAGE(PG8_SB(1, 0), b3, voffB);
            PG8_BAR; PG8_WAIT_L(0); PG8_MMA(0, 1, At, B1); PG8_BAR;
            PG8_LDA(At, 1, 1); PG8_STAGE(PG8_SA(1, 0), a3, voffA);
            PG8_BAR; PG8_WAIT_L(0); PG8_MMA(1, 0, At, B0); PG8_BAR; PG8_SCHED;
            PG8_STAGE(PG8_SB(1, 1), b3 + hstepB, voffB);
            PG8_WAIT_V(6); PG8_BAR; PG8_MMA(1, 1, At, B1); PG8_BAR;
            }
        }
        if constexpr (ALIGN_EPI) { if (wr == 0) PG8_BAR; }
        if constexpr (!Epi::AFTER_DRAIN) { E(acc, cur, wr, wc, fr, fq); S.done(cur); }
        if (!has_next) break;
#pragma unroll
        for (int a = 0; a < 2; ++a)
#pragma unroll
            for (int b = 0; b < 2; ++b)
#pragma unroll
                for (int m = 0; m < 4; ++m)
#pragma unroll
                    for (int n = 0; n < 2; ++n) acc[a][b][m][n] = (f32x4){0.f, 0.f, 0.f, 0.f};
        cur = nxt; cA = nA; cB = nB; ++ui;
        if constexpr (ALIGN_EPI) { if (wr == 1) PG8_BAR; }
    }
    PG8_WAIT_V(0);
    if constexpr (!ALIGN_EPI) { if (wr == 0) PG8_BAR; }
    PG8_BAR;
    if constexpr (Epi::AFTER_DRAIN) { E.fused(acc, cur, wr, wc, fr, fq, lds, wid, lane); S.done(cur); }
#undef PG8_SA
#undef PG8_SB
#undef PG8_STAGE
#undef PG8_LDA
#undef PG8_LDB
#undef PG8_MMA
#undef PG8_WAIT_V
#undef PG8_WAIT_L
#undef PG8_BAR
#undef PG8_SCHED
}
template <class Epi, class Sched>
__device__ __forceinline__ void gemm_phase_gather(PG8_LAS unsigned char* lds, const Gemm g, const Sched& S, const Epi& E) {
    const int tid = threadIdx.x, wid = __builtin_amdgcn_readfirstlane(tid >> 6), lane = tid & 63, wr = wid >> 2, wc = wid & 3, fr = lane & 15, fq = lane >> 4;
    const int K = g.K, nt = K / BK;
    unsigned voffB[2]; int RA[2], CA[2];
#pragma unroll
    for (int i = 0; i < 2; ++i) { int R, C; stage_rc(tid * 16 + i * 8192, R, C); const int Rb = Epi::PERM ? ((R & ~31) + perm32(R & 31)) : R;
        RA[i] = R; CA[i] = C; voffB[i] = (unsigned)(Rb * g.ldb + C) * 2u; }
    const size_t kstep = (size_t)(BK * 2);
    const size_t hstepB = (size_t)HALF * g.ldb * 2, tstepB = 2 * hstepB;
    const unsigned ldsw = (unsigned)wid * 1024u;
    const int aoff = lds_byte(wr * 64 + fr, fq * 8), boff = lds_byte(wc * 32 + fr, fq * 8);
#define PG8_SA(b, h) (((b) * 2 + (h)) * HTB)
#define PG8_SB(b, h) ((4 + (b) * 2 + (h)) * HTB)
#define PG8_STAGE(bufoff, gbase, voff) do { _Pragma("unroll") for (int _i = 0; _i < 2; ++_i) \
        __builtin_amdgcn_global_load_lds((const unsigned*)((const char*)(gbase) + (voff)[_i]), (PG8_LAS unsigned*)(lds + (bufoff) + ldsw + _i * 8192), 16, 0, 0); } while (0)
#define PG8_LDA(dst, b, h) do { _Pragma("unroll") for (int m = 0; m < 4; ++m) _Pragma("unroll") for (int k = 0; k < 2; ++k) dst[m][k] = *(const PG8_LAS bf16x8*)(lds + PG8_SA(b, h) + aoff + m * 2048 + k * 1024); } while (0)
#define PG8_LDB(dst, b, h) do { _Pragma("unroll") for (int n = 0; n < 2; ++n) _Pragma("unroll") for (int k = 0; k < 2; ++k) dst[n][k] = *(const PG8_LAS bf16x8*)(lds + PG8_SB(b, h) + boff + n * 2048 + k * 1024); } while (0)
#define PG8_MMA(ai, bj, At, Bt) do { __builtin_amdgcn_s_setprio(1); _Pragma("unroll") for (int m = 0; m < 4; ++m) _Pragma("unroll") for (int n = 0; n < 2; ++n) _Pragma("unroll") for (int k = 0; k < 2; ++k) \
        acc[ai][bj][m][n] = __builtin_amdgcn_mfma_f32_16x16x32_bf16(Bt[n][k], At[m][k], acc[ai][bj][m][n], 0, 0, 0); __builtin_amdgcn_s_setprio(0); } while (0)
#define PG8_WAIT_V(n) asm volatile("s_waitcnt vmcnt(" #n ")" ::: "memory")
#define PG8_WAIT_L(n) asm volatile("s_waitcnt lgkmcnt(" #n ")" ::: "memory")
#define PG8_BAR __builtin_amdgcn_s_barrier()
#define PG8_SCHED __builtin_amdgcn_sched_barrier(0)
#define PG8_ROWS(dst, ui_) do { _Pragma("unroll") for (int _h = 0; _h < 2; ++_h) _Pragma("unroll") for (int _i = 0; _i < 2; ++_i) \
        dst[_h][_i] = (unsigned)S.row_token((ui_), _h * HALF + RA[_i]) * (unsigned)(g.lda * 2) + (unsigned)(CA[_i] * 2); } while (0)
    Unit cur, nxt; int ui = 0;
    if (!S.next(0, cur)) return;
    f32x4 acc[2][2][4][2];
#pragma unroll
    for (int a = 0; a < 2; ++a)
#pragma unroll
        for (int b = 0; b < 2; ++b)
#pragma unroll
            for (int m = 0; m < 4; ++m)
#pragma unroll
                for (int n = 0; n < 2; ++n) acc[a][b][m][n] = (f32x4){0.f, 0.f, 0.f, 0.f};
    bf16x8 At[4][2], B0[2][2], B1[2][2];
    unsigned offC[2][2];
    PG8_ROWS(offC, 0);
    const char* gA = (const char*)g.A;
    const char* cB = (const char*)g.Bt + (size_t)cur.pn * tstepB;
    PG8_STAGE(PG8_SB(0, 0), cB, voffB); PG8_STAGE(PG8_SB(0, 1), cB + hstepB, voffB); PG8_STAGE(PG8_SA(0, 0), gA, offC[0]); PG8_STAGE(PG8_SA(0, 1), gA, offC[1]);
    if (wr == 1) PG8_BAR;
    PG8_WAIT_V(2); PG8_BAR;
    PG8_STAGE(PG8_SB(1, 0), cB + kstep, voffB); PG8_STAGE(PG8_SA(1, 0), gA + kstep, offC[0]); PG8_STAGE(PG8_SB(1, 1), cB + hstepB + kstep, voffB);
    PG8_WAIT_V(6); PG8_BAR;
    for (;;) {
        const bool has_next = S.next(ui + 1, nxt);
        const char* nB = has_next ? (const char*)g.Bt + (size_t)nxt.pn * tstepB : cB;
        for (int t = 0; t < nt; t += 2) {
            const bool last = (t == nt - 2);
            const char* a1 = gA + (size_t)(t + 1) * kstep;
            const char* a2 = last ? gA : gA + (size_t)(t + 2) * kstep; const char* b2 = last ? nB : cB + (size_t)(t + 2) * kstep;
            const char* a3 = a2 + kstep; const char* b3 = b2 + kstep;
            PG8_LDB(B0, 0, 0); PG8_LDB(B1, 0, 1); PG8_SCHED; PG8_LDA(At, 0, 0); PG8_STAGE(PG8_SA(1, 1), a1, offC[1]);
            if (last && has_next) { PG8_ROWS(offC, ui + 1); }
            PG8_WAIT_V(8); PG8_WAIT_L(0); PG8_BAR; PG8_MMA(0, 0, At, B0); PG8_MMA(0, 1, At, B1); PG8_BAR; PG8_SCHED;
            PG8_LDA(At, 0, 1); PG8_STAGE(PG8_SB(0, 0), b2, voffB); PG8_STAGE(PG8_SB(0, 1), b2 + hstepB, voffB); PG8_STAGE(PG8_SA(0, 0), a2, offC[0]);
            PG8_WAIT_V(8); PG8_WAIT_L(0); PG8_BAR; PG8_MMA(1, 0, At, B0); PG8_MMA(1, 1, At, B1); PG8_BAR; PG8_SCHED;
            PG8_LDB(B0, 1, 0); PG8_LDB(B1, 1, 1); PG8_SCHED; PG8_LDA(At, 1, 0); PG8_STAGE(PG8_SA(0, 1), a2, offC[1]);
            PG8_WAIT_V(8); PG8_WAIT_L(0); PG8_BAR; PG8_MMA(0, 0, At, B0); PG8_MMA(0, 1, At, B1); PG8_BAR; PG8_SCHED;
            PG8_LDA(At, 1, 1); PG8_STAGE(PG8_SB(1, 0), b3, voffB); PG8_STAGE(PG8_SB(1, 1), b3 + hstepB, voffB); PG8_STAGE(PG8_SA(1, 0), a3, offC[0]);
            PG8_WAIT_V(8); PG8_WAIT_L(0); PG8_BAR; PG8_MMA(1, 0, At, B0); PG8_MMA(1, 1, At, B1); PG8_BAR; PG8_SCHED;
        }
        if (wr == 0) PG8_BAR;
        E(acc, cur, wr, wc, fr, fq); S.done(cur);
        if (!has_next) break;
#pragma unroll
        for (int a = 0; a < 2; ++a)
#pragma unroll
            for (int b = 0; b < 2; ++b)
#pragma unroll
                for (int m = 0; m < 4; ++m)
#pragma unroll
                    for (int n = 0; n < 2; ++n) acc[a][b][m][n] = (f32x4){0.f, 0.f, 0.f, 0.f};
        cur = nxt; cB = nB; ++ui;
        if (wr == 1) PG8_BAR;
    }
    PG8_WAIT_V(0);
    PG8_BAR;
#undef PG8_ROWS
#undef PG8_SA
#undef PG8_SB
#undef PG8_STAGE
#undef PG8_LDA
#undef PG8_LDB
#undef PG8_MMA
#undef PG8_WAIT_V
#undef PG8_WAIT_L
#undef PG8_BAR
#undef PG8_SCHED
}
}

constexpr int T = 8192, D = 2048, NL = 2, BW = 512, ZC = 14336, INC = 14352;
constexpr int NE = 64, NEX = 65  , ED = 512;
constexpr int HK = NEX * ED;
constexpr float ALPHA = 1.41421356237f;
constexpr float LN_EPS = 1e-5f;
constexpr int ZC_SBQ = 0, ZC_SBK = 512, ZC_SBV = 1024, ZC_GMU = 1536, ZC_GMV = 2048, ZC_GDN = 2560, ZC_GDNG = 4096,
              ZC_MLQ = 4608, ZC_MLK = 4864, ZC_MLV = 5120, ZC_MLO = 5632, ZC_GATE = 6144;

#define GAS __attribute__((address_space(1)))
#define LAS __attribute__((address_space(3)))
typedef unsigned short bf16;
typedef unsigned v4u __attribute__((ext_vector_type(4)));
typedef unsigned v2u __attribute__((ext_vector_type(2)));
typedef float v4f __attribute__((ext_vector_type(4)));
typedef float v2f __attribute__((ext_vector_type(2)));
#define LDS_WAIT() asm volatile("s_waitcnt lgkmcnt(0)" ::: "memory")

constexpr size_t MiB = 1u << 20;
constexpr size_t WS_CTL = 0, CTL_ZERO_BYTES = 1 * MiB;
constexpr size_t WS_WIN = 2 * MiB, WS_WBR = 58 * MiB, WS_WOUT = 66 * MiB, WS_WUP = 74 * MiB, WS_WDN = 334 * MiB;
constexpr size_t WS_XB = 464 * MiB, WS_SMALL = 496 * MiB, WS_EG = 497 * MiB, WS_BETA = WS_EG + 256 * 1024, WS_COMB = 498 * MiB;
constexpr size_t WS_Z = 500 * MiB, WS_GQ = 724 * MiB, WS_GK = 740 * MiB, WS_GV = 756 * MiB, WS_GO = 772 * MiB, WS_HO = 788 * MiB;
constexpr size_t WS_BR = 804 * MiB, WS_MTMP = 836 * MiB, WS_MSUM = 900 * MiB, WS_Y = 932 * MiB, WS_X1 = 996 * MiB, WS_X1B = 1060 * MiB;
constexpr size_t WS_XCUR = 1092 * MiB, WS_HB = 1156 * MiB, WS_YEXP = 1236 * MiB, WS_LIST = 1524 * MiB, WS_WL = 1526 * MiB, WS_SLOT = 1528 * MiB, WS_MQ = 1530 * MiB, WS_MS = 1534 * MiB, WS_MK = 1538 * MiB, WS_MV = 1542 * MiB, WS_MFL = 1552 * MiB, WS_HDEN = WS_MFL + 65536, WS_END = 1553 * MiB;
constexpr int HROWS = 73728;
static_assert(WS_HB + (size_t)HROWS * ED * 2 <= WS_YEXP && WS_YEXP + (size_t)HROWS * D * 2 <= WS_LIST, "ws map (moe)");
static_assert(WS_WIN + (size_t)ZC * D * 2 <= WS_WBR && WS_WUP + (size_t)NEX * 1024 * D * 2 <= WS_WDN && WS_WDN + (size_t)D * HK * 2 <= WS_XB, "ws map (weights)");
static_assert(WS_Z + (size_t)T * ZC * 2 <= WS_GQ, "ws map (acts)");
constexpr int CW_BAR = 4096, CW_CNT = 16384;
constexpr int TAB_OFF = 131072 + 1024;
constexpr int LDS_BYTES = 147456, MISC_OFF = 131072 + 320;

__device__ __forceinline__ float bflo(unsigned w) { return __uint_as_float(w << 16); }
__device__ __forceinline__ float bfhi(unsigned w) { return __uint_as_float(w & 0xffff0000u); }
__device__ __forceinline__ unsigned f2bf(float f) { unsigned u = __float_as_uint(f); return (u + 0x7fffu + ((u >> 16) & 1u)) >> 16; }
__device__ __forceinline__ unsigned pk2(float lo, float hi) { return f2bf(lo) | (f2bf(hi) << 16); }
template <int CTRL> __device__ __forceinline__ float dpp(float x) { return __builtin_bit_cast(float, __builtin_amdgcn_mov_dpp(__builtin_bit_cast(int, x), CTRL, 0xf, 0xf, true)); }
__device__ __forceinline__ float sum4(float x) { x += dpp<0xB1>(x); x += dpp<0x4E>(x); return x; }
__device__ __forceinline__ float sum8(float x) { x = sum4(x); x += dpp<0x141>(x); return x; }
__device__ __forceinline__ float sum16(float x) { x = sum8(x); x += dpp<0x140>(x); return x; }
__device__ __forceinline__ float wave_sum(float x) { x = sum16(x); x += __shfl_xor(x, 16); x += __shfl_xor(x, 32); return x; }
__device__ __forceinline__ float max8(float x) { x = fmaxf(x, dpp<0xB1>(x)); x = fmaxf(x, dpp<0x4E>(x)); x = fmaxf(x, dpp<0x141>(x)); return x; }
__device__ __forceinline__ float min8(float x) { x = fminf(x, dpp<0xB1>(x)); x = fminf(x, dpp<0x4E>(x)); x = fminf(x, dpp<0x141>(x)); return x; }
__device__ __forceinline__ float wave_scan_incl(float v) {
    v += __builtin_bit_cast(float, __builtin_amdgcn_update_dpp(0, __builtin_bit_cast(int, v), 0x111, 0xf, 0xf, true));
    v += __builtin_bit_cast(float, __builtin_amdgcn_update_dpp(0, __builtin_bit_cast(int, v), 0x112, 0xf, 0xf, true));
    v += __builtin_bit_cast(float, __builtin_amdgcn_update_dpp(0, __builtin_bit_cast(int, v), 0x114, 0xf, 0xf, true));
    v += __builtin_bit_cast(float, __builtin_amdgcn_update_dpp(0, __builtin_bit_cast(int, v), 0x118, 0xf, 0xf, true));
    v += __builtin_bit_cast(float, __builtin_amdgcn_update_dpp(0, __builtin_bit_cast(int, v), 0x142, 0xa, 0xf, false));
    v += __builtin_bit_cast(float, __builtin_amdgcn_update_dpp(0, __builtin_bit_cast(int, v), 0x143, 0xc, 0xf, false));
    return v;
}
__device__ __forceinline__ float sigmoidf_(float x) { return 1.f / (1.f + __expf(-x)); }
__device__ __forceinline__ float siluf_(float x) { return x / (1.f + __expf(-x)); }
__device__ __forceinline__ float softplusf_(float x) { return fmaxf(x, 0.f) + __logf(1.f + __expf(-fabsf(x))); }
__device__ __forceinline__ float gelu_tanh(float x) { const float y = 0.7978845608f * (x + 0.044715f * x * x * x); const float t = 1.f - 2.f / (__expf(2.f * y) + 1.f); return 0.5f * x * (1.f + t); }
__device__ __forceinline__ void unpack8(const v4u r, float (&f)[8]) { f[0] = bflo(r.x); f[1] = bfhi(r.x); f[2] = bflo(r.y); f[3] = bfhi(r.y); f[4] = bflo(r.z); f[5] = bfhi(r.z); f[6] = bflo(r.w); f[7] = bfhi(r.w); }
#define XB_TMO      128
#define XB_XCNT(j)  (256  + 64 * (j))
#define XB_XSUB(j)  (1280 + 64 * (j))
#define XB_XGEN(j)  (2304 + 64 * (j))
#define XB_TOP      3328
#define XB_TOPGEN   3392
#define XCD_BAR_WORDS 3456
#define XB_SPIN_CAP (1u << 18)

__device__ __forceinline__ unsigned xb_ld(unsigned* p)              { return __hip_atomic_load(p, __ATOMIC_RELAXED, __HIP_MEMORY_SCOPE_AGENT); }
__device__ __forceinline__ unsigned xb_add(unsigned* p, unsigned v) { return __hip_atomic_fetch_add(p, v, __ATOMIC_RELAXED, __HIP_MEMORY_SCOPE_AGENT); }
__device__ __forceinline__ unsigned xb_xcc_id() { return (unsigned)__builtin_amdgcn_s_getreg((3 << 11) | 20) & 0xFu; }
#define XB_SPIN(cond, bar) do { unsigned _sp = 0; while (cond) { __builtin_amdgcn_s_sleep(1); \
    if ((++_sp & 255u) == 0u) { if (xb_ld(&(bar)[XB_TMO])) break; if (_sp > XB_SPIN_CAP) { atomicAdd(&(bar)[XB_TMO], 1u); break; } } } } while (0)

struct XcdBarrier {
    unsigned* bar; unsigned x;
    volatile LAS unsigned* st;
};

__device__ __forceinline__ XcdBarrier xcd_barrier_post(unsigned* bar, volatile LAS unsigned* st) {
    XcdBarrier b; b.bar = bar; b.x = xb_xcc_id(); b.st = st;
    if (threadIdx.x == 0) (void)xb_add(&bar[XB_XCNT(b.x)], 1u);
    return b;
}
__device__ __forceinline__ void xcd_barrier_complete(unsigned* bar, unsigned x, unsigned& nloc, unsigned& nx) {
    const unsigned G = gridDim.x * gridDim.y * gridDim.z;
    unsigned sum, cnt, mine, sp = 0u;
    for (;;) {
        sum = 0u; cnt = 0u; mine = 0u;
#pragma unroll
        for (unsigned j = 0; j < 16; ++j) { const unsigned c = xb_ld(&bar[XB_XCNT(j)]); sum += c; cnt += (c > 0u) ? 1u : 0u; mine = (j == x) ? c : mine; }
        if (sum == G) break;
        __builtin_amdgcn_s_sleep(1);
        if ((++sp & 255u) == 0u) { if (xb_ld(&bar[XB_TMO])) break; if (sp > XB_SPIN_CAP) { atomicAdd(&bar[XB_TMO], 1u); break; } }
    }
    nloc = mine > 0u ? mine : 1u; nx = cnt > 0u ? cnt : 1u;
}

__device__ __forceinline__ void xcd_barrier(const XcdBarrier& b) {
    asm volatile("s_waitcnt vmcnt(0)" ::: "memory");
    __syncthreads();
    if (threadIdx.x == 0) {
        unsigned* bar = b.bar;
        __builtin_amdgcn_s_waitcnt(0);
        unsigned nloc = b.st[0], nx = b.st[1];
        if (nloc == 0u) { xcd_barrier_complete(bar, b.x, nloc, nx); b.st[0] = nloc; b.st[1] = nx; }
        const unsigned old = xb_add(&bar[XB_XSUB(b.x)], 1u);
        const unsigned gen = old / nloc;
        if (old + 1u == (gen + 1u) * nloc) {
            __builtin_amdgcn_fence(__ATOMIC_RELEASE, "agent");
            asm volatile("s_waitcnt vmcnt(0)" ::: "memory");
            const unsigned og = xb_add(&bar[XB_TOP], 1u);
            const unsigned tg = og / nx;
            if (og + 1u == (tg + 1u) * nx) xb_add(&bar[XB_TOPGEN], 1u);
            else XB_SPIN(xb_ld(&bar[XB_TOPGEN]) == tg, bar);
            __builtin_amdgcn_fence(__ATOMIC_ACQUIRE, "agent");
            xb_add(&bar[XB_XGEN(b.x)], 1u);
            asm volatile("s_waitcnt vmcnt(0)" ::: "memory");
        } else {
            XB_SPIN(xb_ld(&bar[XB_XGEN(b.x)]) == gen, bar);
            __builtin_amdgcn_fence(__ATOMIC_ACQUIRE, "agent");
            asm volatile("s_waitcnt vmcnt(0)" ::: "memory");
        }
    }
    __syncthreads();
}

struct Params { const float* in[27]; float* out; unsigned char* ws; int ph_lo, ph_hi; };
enum { I_X = 0, I_WIN, I_GMNG, I_GMNB, I_GMWS, I_GMBS, I_CONVW, I_ALOG, I_DTB, I_GDNNG, I_MLIB, I_MLFB, I_MLNG, I_WBR, I_WOUT, I_LN1G, I_LN1B,
       I_WR, I_RB, I_WG, I_WU, I_WD, I_SG, I_SU, I_SD, I_LN2G, I_LN2B };

using pg8::f32x4; using pg8::u32x4; using pg8::Unit; using pg8::HALF; using pg8::BM;

struct MergeOrder {
    int G, c;
    __device__ bool next(int i, Unit& u) const {
        const long L = (long)(i >> 2) * G + c; if (L >= 256) return false;
        const int g = i & 3; int wgid = (int)L; { const int q = 256 / 8, xcd = wgid % 8, off = wgid / 8; wgid = xcd * q + off; }
        const int nN = 8, nig = 8 * nN, gid = wgid / nig, fm = gid * 8; const int pm = fm + ((wgid % nig) % 8), pn = (wgid % nig) / 8;
        u.pm = g * 32 + pm; u.pn = g * 8 + pn; return true;
    }
    __device__ __forceinline__ void a_ready(const Unit&) const {}
    __device__ __forceinline__ void done(const Unit&) const {}
};
struct EpiMerge {
    static constexpr bool PERM = true, AFTER_DRAIN = false;
    const bf16* Z; float* tmp; bf16* msum;
    __device__ __forceinline__ void operator()(const f32x4 (&acc)[2][2][4][2], const Unit& u, int wr, int wc, int fr, int fq) const {
        const int g = u.pm >> 5, pm = u.pm & 31, pn = u.pn & 7;
        const int row0 = pm * BM + wr * 64 + fr, col0 = pn * BM + wc * 32 + 8 * fq;
#pragma unroll
        for (int ai = 0; ai < 2; ++ai)
#pragma unroll
            for (int m = 0; m < 4; ++m) { const size_t row = (size_t)(row0 + ai * HALF + m * 16);
#pragma unroll
                for (int bj = 0; bj < 2; ++bj) { const int col = col0 + bj * HALF;
                    const v4u gr = *(const v4u*)(Z + row * ZC + ZC_GATE + g * D + col); float gl[8]; unpack8(gr, gl);
                    float* tp = tmp + row * D + col; f32x4 v0 = acc[ai][bj][m][0], v1 = acc[ai][bj][m][1];
#pragma unroll
                    for (int j = 0; j < 4; ++j) { v0[j] *= sigmoidf_(gl[j]); v1[j] *= sigmoidf_(gl[4 + j]); }
                    if (g > 0) { v0 += *(const f32x4*)tp; v1 += *(const f32x4*)(tp + 4); }
                    if (g < 3) { *(f32x4*)tp = v0; *(f32x4*)(tp + 4) = v1; }
                    else { u32x4 w; w.x = pk2(v0[0], v0[1]); w.y = pk2(v0[2], v0[3]); w.z = pk2(v1[0], v1[1]); w.w = pk2(v1[2], v1[3]); *(u32x4*)(msum + row * D + col) = w; } }
                asm volatile("" ::: "memory"); }
    }
};
struct EpiResid {
    static constexpr bool PERM = false, AFTER_DRAIN = false;
    const float* X; float* Y;
    __device__ __forceinline__ void operator()(const f32x4 (&acc)[2][2][4][2], const Unit& u, int wr, int wc, int fr, int fq) const {
        const int row0 = u.pm * BM + wr * 64 + fr, col0 = u.pn * BM + wc * 32 + 4 * fq;
#pragma unroll
        for (int ai = 0; ai < 2; ++ai)
#pragma unroll
            for (int m = 0; m < 4; ++m) { const size_t off = (size_t)(row0 + ai * HALF + m * 16) * D + col0;
#pragma unroll
                for (int bj = 0; bj < 2; ++bj)
#pragma unroll
                    for (int n = 0; n < 2; ++n) { const f32x4 xv = *(const f32x4*)(X + off + bj * HALF + n * 16); *(f32x4*)(Y + off + bj * HALF + n * 16) = xv * ALPHA + acc[ai][bj][m][n]; } }
    }
};
struct MoeTab {
    LAS int* t; LAS unsigned short* tok; LAS float* wt; LAS unsigned char* mte;
    __device__ __forceinline__ MoeTab(LAS unsigned char* lds) : t((LAS int*)(lds + TAB_OFF)), tok((LAS unsigned short*)(lds + TAB_OFF + 1024)), wt((LAS float*)(lds + TAB_OFF + 5120)), mte((LAS unsigned char*)(lds + TAB_OFF + 13312)) {}
};
__device__ __forceinline__ void moe_tables(const MoeTab& M, const unsigned* cnt  , int tid, int lane, int wave) {
    __syncthreads();
    if (wave == 0) { const int c = (int)cnt[64 * lane]; const int tiles = (c + 255) >> 8; const float incl = wave_scan_incl((float)tiles);
        M.t[80 + lane] = c; M.t[lane] = (int)incl - tiles; if (lane == 63) { M.t[64] = (int)incl; M.t[65] = (int)incl + T / 256; M.t[80 + 64] = T; } }
    __syncthreads();
    const int Mt = M.t[65];
    for (int mt = tid; mt < Mt; mt += 512) { int e = 0;
        for (int k = 1; k <= 64; ++k) e = (M.t[k] <= mt) ? k : e;
        M.mte[mt] = (unsigned char)e; }
    __syncthreads();
}
struct UpOrder {
    MoeTab M; int n;
    __device__ __forceinline__ bool next(int i, Unit& u) const { if (i >= n) return false; u.pm = M.t[168 + i]; u.pn = M.t[176 + i]; u.aux = i; return true; }
    __device__ __forceinline__ int row_token(int i, int r) const { return (int)M.tok[i * 256 + r]; }
    __device__ __forceinline__ void a_ready(const Unit&) const {}
    __device__ __forceinline__ void done(const Unit&) const {}
};
__device__ __forceinline__ int up_order_build(const MoeTab& M, const int* LIST, const float* WL, int wg, int G, int tid) {
    const int U = 4 * M.t[65];
    if (tid < 8) { const int L = tid * G + wg; if (L < U) { const int mt = L >> 2, q = L & 3, e = M.mte[mt]; M.t[168 + tid] = mt; M.t[176 + tid] = e * 4 + q; M.t[184 + tid] = e; M.t[192 + tid] = mt - M.t[e]; } }
    int n = 0;
#pragma unroll
    for (int i = 0; i < 8; ++i) n += (i * G + wg < U) ? 1 : 0;
    __syncthreads();
    for (int idx = tid; idx < n * 256; idx += 512) { const int i = idx >> 8, r = idx & 255, e = M.t[184 + i], li = M.t[192 + i] * 256 + r;
        int tk = 0; float w = 0.f;
        if (e < NE) { if (li < M.t[80 + e]) { tk = LIST[e * T + li]; w = WL[e * T + li]; } } else { tk = li; w = 1.f; }
        M.tok[idx] = (unsigned short)tk; M.wt[idx] = w; }
    __syncthreads();
    return n;
}
struct EpiGluSparse {
    static constexpr bool PERM = true, AFTER_DRAIN = false;
    LAS const float* wt; bf16* H;
    __device__ __forceinline__ void operator()(const f32x4 (&acc)[2][2][4][2], const Unit& u, int wr, int wc, int fr, int fq) const {
        const int q = u.pn & 3; const int rl0 = wr * 64 + fr, col0 = q * 128 + wc * 32 + 8 * fq;
#pragma unroll
        for (int ai = 0; ai < 2; ++ai)
#pragma unroll
            for (int m = 0; m < 4; ++m) { const int rl = rl0 + ai * HALF + m * 16; const float c = wt[u.aux * 256 + rl]; float h[8];
#pragma unroll
                for (int n = 0; n < 2; ++n)
#pragma unroll
                    for (int j = 0; j < 4; ++j) h[4 * n + j] = siluf_(acc[ai][0][m][n][j]) * acc[ai][1][m][n][j] * c;
                u32x4 w; w.x = pk2(h[0], h[1]); w.y = pk2(h[2], h[3]); w.z = pk2(h[4], h[5]); w.w = pk2(h[6], h[7]);
                *(u32x4*)(H + ((size_t)u.pm * 256 + rl) * ED + col0) = w; }
    }
};
struct DownOrder {
    MoeTab M; int G, c, U;
    __device__ __forceinline__ bool next(int i, Unit& u) const { const int L = i * G + c; if (L >= U) return false; const int mt = L >> 3; u.pm = mt; u.pn = (int)M.mte[mt] * 8 + (L & 7); u.aux = 0; return true; }
    __device__ __forceinline__ void a_ready(const Unit&) const {}
    __device__ __forceinline__ void done(const Unit&) const {}
};
struct EpiYexp {
    static constexpr bool PERM = true, AFTER_DRAIN = false;
    bf16* Y;
    __device__ __forceinline__ void operator()(const f32x4 (&acc)[2][2][4][2], const Unit& u, int wr, int wc, int fr, int fq) const {
        const int row0 = u.pm * BM + wr * 64 + fr, col0 = (u.pn & 7) * BM + wc * 32 + 8 * fq;
#pragma unroll
        for (int ai = 0; ai < 2; ++ai)
#pragma unroll
            for (int m = 0; m < 4; ++m) { bf16* rowp = Y + (size_t)(row0 + ai * HALF + m * 16) * D + col0;
#pragma unroll
                for (int bj = 0; bj < 2; ++bj) { const f32x4 v0 = acc[ai][bj][m][0], v1 = acc[ai][bj][m][1];
                    u32x4 w; w.x = pk2(v0[0], v0[1]); w.y = pk2(v0[2], v0[3]); w.z = pk2(v1[0], v1[1]); w.w = pk2(v1[2], v1[3]); *(u32x4*)(rowp + bj * HALF) = w; } }
    }
};

__device__ __forceinline__ void tr_item(const float* src, size_t sld, bf16* dst, size_t dld, LAS float* scr, int lane) {
#pragma unroll 8
    for (int i = 0; i < 32; ++i) { const int kk = 2 * i + (lane >> 5); scr[kk * 33 + (lane & 31)] = src[(size_t)kk * sld + (lane & 31)]; }
    LDS_WAIT(); asm volatile("" ::: "memory");
    const int c = lane & 7;
#pragma unroll
    for (int j = 0; j < 4; ++j) { const int n = (lane >> 3) + 8 * j; const LAS float* s = scr + (8 * c) * 33 + n;
        v4u o; o.x = pk2(s[0 * 33], s[1 * 33]); o.y = pk2(s[2 * 33], s[3 * 33]); o.z = pk2(s[4 * 33], s[5 * 33]); o.w = pk2(s[6 * 33], s[7 * 33]);
        *(v4u*)(dst + (size_t)n * dld + 8 * c) = o; }
    LDS_WAIT(); asm volatile("" ::: "memory");
}
__device__ __forceinline__ void phase_convert(const Params& p, int l, LAS unsigned char* lds, int gw, int NGW, int wave, int lane) {
    unsigned char* ws = p.ws;
    const float* w_in = p.in[I_WIN] + (size_t)l * D * INC; const float* w_br = p.in[I_WBR] + (size_t)l * 4 * BW * D; const float* w_out = p.in[I_WOUT] + (size_t)l * D * D;
    const float* w_g = p.in[I_WG] + (size_t)l * NE * D * ED; const float* w_u = p.in[I_WU] + (size_t)l * NE * D * ED; const float* w_d = p.in[I_WD] + (size_t)l * NE * ED * D;
    const float* s_g = p.in[I_SG] + (size_t)l * D * ED; const float* s_u = p.in[I_SU] + (size_t)l * D * ED; const float* s_d = p.in[I_SD] + (size_t)l * ED * D;
    bf16* WIN = (bf16*)(ws + WS_WIN); bf16* WBR = (bf16*)(ws + WS_WBR); bf16* WOUT = (bf16*)(ws + WS_WOUT); bf16* WUP = (bf16*)(ws + WS_WUP); bf16* WDN = (bf16*)(ws + WS_WDN);
    LAS float* scr = (LAS float*)(lds + wave * 16384);
    constexpr int N_IN = (ZC / 32) * (D / 64), N_BR = 4 * (BW / 64) * (D / 32), N_OUT = (D / 64) * (D / 32), N_UP = NEX * 2 * (D / 64) * (ED / 32), N_DN = NEX * (ED / 64) * (D / 32);
    constexpr int NITEMS = N_IN + N_BR + N_OUT + N_UP + N_DN;
    for (int it = gw; it < NITEMS; it += NGW) {
        int r = it;
        if (r < N_IN) { const int kb = r / (ZC / 32), n0 = (r % (ZC / 32)) * 32, k0 = kb * 64; const int sc = n0 + (n0 >= ZC_GATE ? 16 : (n0 >= ZC_MLQ ? 8 : 0));
            tr_item(w_in + (size_t)k0 * INC + sc, INC, WIN + (size_t)n0 * D + k0, D, scr, lane); continue; } r -= N_IN;
        if (r < N_BR) { const int g = r / 512, rr = r % 512, k0 = (rr / 64) * 64, n0 = (rr % 64) * 32;
            tr_item(w_br + ((size_t)g * BW + k0) * D + n0, D, WBR + ((size_t)g * D + n0) * BW + k0, BW, scr, lane); continue; } r -= N_BR;
        if (r < N_OUT) { const int k0 = (r / 64) * 64, n0 = (r % 64) * 32;
            tr_item(w_out + (size_t)k0 * D + n0, D, WOUT + (size_t)n0 * D + k0, D, scr, lane); continue; } r -= N_OUT;
        if (r < N_UP) { const int e = r / 1024, rr = r % 1024, mat = rr / 512, r2 = rr % 512, k0 = (r2 / 16) * 64, n0 = (r2 % 16) * 32;
            const float* sb = (e < NE) ? ((mat ? w_u : w_g) + (size_t)e * D * ED) : (mat ? s_u : s_g);
            const int drow = e * 1024 + (n0 / 128) * 256 + mat * 128 + (n0 % 128);
            tr_item(sb + (size_t)k0 * ED + n0, ED, WUP + (size_t)drow * D + k0, D, scr, lane); continue; } r -= N_UP;
        { const int e = r / 512, rr = r % 512, k0 = (rr / 64) * 64, n0 = (rr % 64) * 32;
            const float* sb = (e < NE) ? (w_d + (size_t)e * ED * D) : s_d;
            tr_item(sb + (size_t)k0 * D + n0, D, WDN + ((size_t)e * D + n0) * ED + k0, ED, scr, lane); }
    }
}
__device__ __forceinline__ void phase_xprep(const Params& p, int l, const float* xin, LAS unsigned char* lds, int gw, int NGW, int tid, int lane) {
    const float* w_in = p.in[I_WIN] + (size_t)l * D * INC; LAS float* wsm = (LAS float*)lds;
    __syncthreads();
    for (int idx = tid; idx < D * 16; idx += 512) { const int d = idx >> 4, c = idx & 15; wsm[c * D + d] = w_in[(size_t)d * INC + (c < 8 ? 4608 + c : 6152 + (c - 8))]; }
    __syncthreads();
    bf16* XB = (bf16*)(p.ws + WS_XB); float* SMALL = (float*)(p.ws + WS_SMALL);
    for (int m = gw; m < T; m += NGW) {
        const v4f* xr = (const v4f*)(xin + (size_t)m * D) + lane; v4f v[8];
#pragma unroll
        for (int j = 0; j < 8; ++j) v[j] = xr[64 * j];
        v2u* xo = (v2u*)(XB + (size_t)m * D) + lane;
#pragma unroll
        for (int j = 0; j < 8; ++j) { v2u o; o.x = pk2(v[j].x, v[j].y); o.y = pk2(v[j].z, v[j].w); xo[64 * j] = o; }
        float res = 0.f;
#pragma unroll 1
        for (int c = 0; c < 16; ++c) { float a = 0.f;
#pragma unroll
            for (int j = 0; j < 8; ++j) { const v4f w = *(const LAS v4f*)(wsm + c * D + 4 * lane + 256 * j); a += v[j].x * w.x + v[j].y * w.y + v[j].z * w.z + v[j].w * w.w; }
            a = wave_sum(a); if (lane == c) res = a; }
        if (lane < 16) SMALL[(size_t)m * 16 + lane] = res;
    }
    __syncthreads();
}

__device__ __forceinline__ void phase_gdn_prep(const Params& p, int l, int gw, int NGW, int lane) {
    const bf16* Z = (const bf16*)(p.ws + WS_Z); const float* SMALL = (const float*)(p.ws + WS_SMALL);
    float* GQ = (float*)(p.ws + WS_GQ); float* GK = (float*)(p.ws + WS_GK); float* GV = (float*)(p.ws + WS_GV); float* EG = (float*)(p.ws + WS_EG); float* BETA = (float*)(p.ws + WS_BETA);
    const float* cw = p.in[I_CONVW] + (size_t)l * 4 * 1536;
    for (int t = gw; t < T; t += NGW) {
#pragma unroll
        for (int i = 0; i < 3; ++i) {
            float a[8];
#pragma unroll
            for (int e = 0; e < 8; ++e) a[e] = 0.f;
#pragma unroll
            for (int j = 0; j < 4; ++j) { const int tt = t - 3 + j; if (tt >= 0) {
                const v4u raw = *(const v4u*)(Z + (size_t)tt * ZC + ZC_GDN + i * 512 + 8 * lane); float x[8]; unpack8(raw, x);
                const v4f w0 = *(const v4f*)(cw + j * 1536 + i * 512 + 8 * lane), w1 = *(const v4f*)(cw + j * 1536 + i * 512 + 8 * lane + 4);
                a[0] += w0.x * x[0]; a[1] += w0.y * x[1]; a[2] += w0.z * x[2]; a[3] += w0.w * x[3]; a[4] += w1.x * x[4]; a[5] += w1.y * x[5]; a[6] += w1.z * x[6]; a[7] += w1.w * x[7]; } }
            float ss = 0.f;
#pragma unroll
            for (int e = 0; e < 8; ++e) { a[e] = siluf_(a[e]); ss += a[e] * a[e]; }
            if (i < 2) { ss = sum16(ss); const float r = rsqrtf(ss + 1e-6f) * (i == 0 ? 0.08838834764831845f : 1.f);
#pragma unroll
                for (int e = 0; e < 8; ++e) a[e] *= r; }
            float* dst = (i == 0 ? GQ : (i == 1 ? GK : GV)) + (size_t)t * BW + 8 * lane;
            *(v4f*)dst = (v4f){a[0], a[1], a[2], a[3]}; *(v4f*)(dst + 4) = (v4f){a[4], a[5], a[6], a[7]};
        }
        if (lane < 4) { const float b = SMALL[(size_t)t * 16 + lane], a = SMALL[(size_t)t * 16 + 4 + lane];
            const float g = -__expf(p.in[I_ALOG][l * 4 + lane]) * softplusf_(a + p.in[I_DTB][l * 4 + lane]);
            EG[(size_t)t * 4 + lane] = __expf(g); BETA[(size_t)t * 4 + lane] = sigmoidf_(b); }
    }
}

__device__ __forceinline__ void mixer_gdn_scan(const Params& p, LAS unsigned char* lds, int wgi, int tid, int wave, int lane) {
    const int h = wgi >> 1, half = wgi & 1, el = wave * 8 + (lane >> 3), j = lane & 7;
    const float* GQ = (const float*)(p.ws + WS_GQ); const float* GK = (const float*)(p.ws + WS_GK); const float* GV = (const float*)(p.ws + WS_GV);
    const float* EG = (const float*)(p.ws + WS_EG); const float* BETA = (const float*)(p.ws + WS_BETA); float* GO = (float*)(p.ws + WS_GO);
    LAS float* kb = (LAS float*)lds;
    LAS float* qb = (LAS float*)(lds + 32768);
    LAS float* vb = (LAS float*)(lds + 65536);
    LAS float* sb = (LAS float*)(lds + 81920);
    float S[16];
#pragma unroll
    for (int i = 0; i < 16; ++i) S[i] = 0.f;
    v4f rk[2], rq[2], rv; float rs = 0.f;
    auto gload = [&](int c) { const size_t t0 = (size_t)c * 32;
#pragma unroll
        for (int r = 0; r < 2; ++r) { const int idx = tid + 512 * r, tk = idx >> 5, c4 = idx & 31; rk[r] = *(const v4f*)(GK + (t0 + tk) * BW + h * 128 + 4 * c4); rq[r] = *(const v4f*)(GQ + (t0 + tk) * BW + h * 128 + 4 * c4); }
        { const int tk = tid >> 4, c4 = tid & 15; rv = *(const v4f*)(GV + (t0 + tk) * BW + h * 128 + half * 64 + 4 * c4); }
        if (tid < 32) rs = EG[(t0 + tid) * 4 + h]; else if (tid < 64) rs = BETA[(t0 + tid - 32) * 4 + h]; };
    auto lwrite = [&](int b) {
#pragma unroll
        for (int r = 0; r < 2; ++r) { const int idx = tid + 512 * r; *(LAS v4f*)(kb + b * 4096 + 4 * idx) = rk[r]; *(LAS v4f*)(qb + b * 4096 + 4 * idx) = rq[r]; }
        *(LAS v4f*)(vb + b * 2048 + 4 * tid) = rv; if (tid < 64) sb[b * 64 + tid] = rs; };
    gload(0); lwrite(0); __syncthreads();
    for (int c = 0; c < T / 32; ++c) {
        const int cur = c & 1;
        if (c + 1 < T / 32) gload(c + 1);
#pragma unroll 4
        for (int tk = 0; tk < 32; ++tk) {
            float k[16], q[16];
#pragma unroll
            for (int i = 0; i < 4; ++i) { const v4f a = *(const LAS v4f*)(kb + cur * 4096 + tk * 128 + 16 * j + 4 * i); k[4 * i] = a.x; k[4 * i + 1] = a.y; k[4 * i + 2] = a.z; k[4 * i + 3] = a.w;
                                          const v4f b = *(const LAS v4f*)(qb + cur * 4096 + tk * 128 + 16 * j + 4 * i); q[4 * i] = b.x; q[4 * i + 1] = b.y; q[4 * i + 2] = b.z; q[4 * i + 3] = b.w; }
            const float v = vb[cur * 2048 + tk * 64 + el], eg = sb[cur * 64 + tk], be = sb[cur * 64 + 32 + tk];
            float ks = 0.f;
#pragma unroll
            for (int i = 0; i < 16; ++i) ks += k[i] * S[i];
            ks = sum8(ks);
            const float vn = be * (v - eg * ks);
            float o = 0.f;
#pragma unroll
            for (int i = 0; i < 16; ++i) { S[i] = eg * S[i] + k[i] * vn; o += q[i] * S[i]; }
            o = sum8(o);
            if (j == 0) GO[((size_t)c * 32 + tk) * BW + h * 128 + half * 64 + el] = o;
        }
        if (c + 1 < T / 32) lwrite(cur ^ 1);
        __syncthreads();
    }
}
__device__ __forceinline__ void mixer_mlstm_scan(const Params& p, int l, LAS unsigned char* lds, int h, int tid, int wave, int lane) {
    const int e = wave * 16 + (lane >> 2), j = lane & 3;
    const bf16* Z = (const bf16*)(p.ws + WS_Z); const float* SMALL = (const float*)(p.ws + WS_SMALL); float* HO = (float*)(p.ws + WS_HO);
    const float ib = p.in[I_MLIB][l * 4 + h], fb = p.in[I_MLFB][l * 4 + h];
    LAS float* qb = (LAS float*)lds;
    LAS float* kb = (LAS float*)(lds + 16384);
    LAS float* vb = (LAS float*)(lds + 32768);
    LAS float* sb = (LAS float*)(lds + 65536);
    float Cm[16], nv[16];
#pragma unroll
    for (int i = 0; i < 16; ++i) { Cm[i] = 0.f; nv[i] = 0.f; }
    v4u rqk, rv; float rs = 0.f;
    auto gload = [&](int c) { const size_t t0 = (size_t)c * 32;
        { const int tt = tid & 255, tk = tt >> 3, c8 = tt & 7; rqk = *(const v4u*)(Z + (t0 + tk) * ZC + (tid < 256 ? ZC_MLQ : ZC_MLK) + h * 64 + 8 * c8); }
        { const int tk = tid >> 4, c8 = tid & 15; rv = *(const v4u*)(Z + (t0 + tk) * ZC + ZC_MLV + h * 128 + 8 * c8); }
        if (tid < 32) rs = sigmoidf_(SMALL[(t0 + tid) * 16 + 12 + h] + fb); else if (tid < 64) rs = __expf(SMALL[(t0 + tid - 32) * 16 + 8 + h] + ib); };
    auto lwrite = [&](int b) { float f[8];
        unpack8(rqk, f); { const int tt = tid & 255; const float sc = tid < 256 ? 0.125f : 1.f; LAS float* dst = (tid < 256 ? qb : kb) + b * 2048 + 8 * tt;
            *(LAS v4f*)dst = (v4f){f[0] * sc, f[1] * sc, f[2] * sc, f[3] * sc}; *(LAS v4f*)(dst + 4) = (v4f){f[4] * sc, f[5] * sc, f[6] * sc, f[7] * sc}; }
        unpack8(rv, f); { LAS float* dst = vb + b * 4096 + 8 * tid; *(LAS v4f*)dst = (v4f){f[0], f[1], f[2], f[3]}; *(LAS v4f*)(dst + 4) = (v4f){f[4], f[5], f[6], f[7]}; }
        if (tid < 64) sb[b * 64 + tid] = rs; };
    gload(0); lwrite(0); __syncthreads();
    for (int c = 0; c < T / 32; ++c) {
        const int cur = c & 1;
        if (c + 1 < T / 32) gload(c + 1);
#pragma unroll 4
        for (int tk = 0; tk < 32; ++tk) {
            float k[16], q[16];
#pragma unroll
            for (int i = 0; i < 4; ++i) { const v4f a = *(const LAS v4f*)(kb + cur * 2048 + tk * 64 + 16 * j + 4 * i); k[4 * i] = a.x; k[4 * i + 1] = a.y; k[4 * i + 2] = a.z; k[4 * i + 3] = a.w;
                                          const v4f b = *(const LAS v4f*)(qb + cur * 2048 + tk * 64 + 16 * j + 4 * i); q[4 * i] = b.x; q[4 * i + 1] = b.y; q[4 * i + 2] = b.z; q[4 * i + 3] = b.w; }
            const float v = vb[cur * 4096 + tk * 128 + e], f = sb[cur * 64 + tk], ig = sb[cur * 64 + 32 + tk];
            const float iv = ig * v; float num = 0.f, den = 0.f;
#pragma unroll
            for (int i = 0; i < 16; ++i) { Cm[i] = f * Cm[i] + iv * k[i]; nv[i] = f * nv[i] + ig * k[i]; num += q[i] * Cm[i]; den += q[i] * nv[i]; }
            num = sum4(num); den = sum4(den);
            if (j == 0) HO[((size_t)c * 32 + tk) * BW + h * 128 + e] = num / fmaxf(fabsf(den), 1.f);
        }
        if (c + 1 < T / 32) lwrite(cur ^ 1);
        __syncthreads();
    }
}

typedef short bf16x8_t __attribute__((ext_vector_type(8)));
__device__ __forceinline__ void ml_pre_item(const Params& p, int l, LAS unsigned char* lds, int item, int tid, int wave, int lane) {
    const int h = item & 3, n = item >> 2; const size_t t0 = (size_t)n * 64;
    const bf16* Z = (const bf16*)(p.ws + WS_Z); const float* SMALL = (const float*)(p.ws + WS_SMALL);
    bf16* MQ = (bf16*)(p.ws + WS_MQ) + (size_t)item * 4096; bf16* MS = (bf16*)(p.ws + WS_MS) + (size_t)item * 4096; bf16* MK = (bf16*)(p.ws + WS_MK) + (size_t)item * 4096;
    bf16* MV = (bf16*)(p.ws + WS_MV) + (size_t)item * 9216; float* MFL = (float*)(p.ws + WS_MFL);
    LAS float* qs = (LAS float*)lds;
    LAS float* ks = qs + 64 * 65;
    LAS float* bs = ks + 64 * 65;
    LAS unsigned short* vs = (LAS unsigned short*)(bs + 128);
    { const int tk = tid >> 3, c8 = tid & 7; float f[8];
      unpack8(*(const v4u*)(Z + (t0 + tk) * ZC + ZC_MLQ + h * 64 + 8 * c8), f);
#pragma unroll
      for (int i = 0; i < 8; ++i) qs[tk * 65 + 8 * c8 + i] = f[i];
      unpack8(*(const v4u*)(Z + (t0 + tk) * ZC + ZC_MLK + h * 64 + 8 * c8), f);
#pragma unroll
      for (int i = 0; i < 8; ++i) ks[tk * 65 + 8 * c8 + i] = f[i]; }
#pragma unroll
    for (int r = 0; r < 2; ++r) { const int idx = tid + 512 * r, tk = idx >> 4, c8 = idx & 15;
        *(LAS v4u*)(vs + tk * 136 + 8 * c8) = *(const v4u*)(Z + (t0 + tk) * ZC + ZC_MLV + h * 128 + 8 * c8); }
    if (wave == 0) { const float fp = SMALL[(t0 + lane) * 16 + 12 + h] + p.in[I_MLFB][l * 4 + h]; const float lf = -softplusf_(-fp);
        bs[lane] = wave_scan_incl(lf); bs[64 + lane] = SMALL[(t0 + lane) * 16 + 8 + h] + p.in[I_MLIB][l * 4 + h]; }
    __syncthreads();
    const float blast = bs[63];
    { const int i = tid >> 3, jb = tid & 7; const float bi = bs[i];
      { const float e = __expf(bi) * 0.125f; float o[8];
#pragma unroll
        for (int x = 0; x < 8; ++x) o[x] = qs[i * 65 + 8 * jb + x] * e;
        v4u w; w.x = pk2(o[0], o[1]); w.y = pk2(o[2], o[3]); w.z = pk2(o[4], o[5]); w.w = pk2(o[6], o[7]); *(v4u*)(MQ + i * 64 + 8 * jb) = w; }
      { float d[8];
#pragma unroll
        for (int x = 0; x < 8; ++x) d[x] = 0.f;
        if (8 * jb <= i) {
            for (int dd = 0; dd < 64; ++dd) { const float qv = qs[i * 65 + dd];
#pragma unroll
                for (int x = 0; x < 8; ++x) d[x] += qv * ks[(8 * jb + x) * 65 + dd]; }
#pragma unroll
            for (int x = 0; x < 8; ++x) { const int j = 8 * jb + x; d[x] = (j <= i) ? __expf(bi - bs[j] + bs[64 + j]) * d[x] * 0.125f : 0.f; } }
        v4u w; w.x = pk2(d[0], d[1]); w.y = pk2(d[2], d[3]); w.z = pk2(d[4], d[5]); w.w = pk2(d[6], d[7]); *(v4u*)(MS + i * 64 + 8 * jb) = w; }
      { float o[8];
#pragma unroll
        for (int x = 0; x < 8; ++x) { const int j = 8 * jb + x; o[x] = ks[j * 65 + i] * __expf(blast - bs[j] + bs[64 + j]); }
        v4u w; w.x = pk2(o[0], o[1]); w.y = pk2(o[2], o[3]); w.z = pk2(o[4], o[5]); w.w = pk2(o[6], o[7]); *(v4u*)(MK + i * 64 + 8 * jb) = w; }
    }
    { const int c = tid >> 2, jq = tid & 3; unsigned w[8];
#pragma unroll
      for (int x = 0; x < 8; ++x) w[x] = (unsigned)vs[(16 * jq + 2 * x) * 136 + c] | ((unsigned)vs[(16 * jq + 2 * x + 1) * 136 + c] << 16);
      *(v4u*)(MV + c * 64 + 16 * jq) = (v4u){w[0], w[1], w[2], w[3]}; *(v4u*)(MV + c * 64 + 16 * jq + 8) = (v4u){w[4], w[5], w[6], w[7]};
      if (tid < 64) { const int c2 = 128 + (tid >> 2); const unsigned one = (c2 == 128) ? 0x3F803F80u : 0u;
          *(v4u*)(MV + c2 * 64 + 16 * jq) = (v4u){one, one, one, one}; *(v4u*)(MV + c2 * 64 + 16 * jq + 8) = (v4u){one, one, one, one}; } }
    if (tid == 0) MFL[item] = __expf(blast);
    __syncthreads();
}
struct MlFrags { bf16x8_t q[2], s[2], kt[2], vt[2]; float fl; };
__device__ __forceinline__ void ml_load(MlFrags& F, const Params& p, int item, int offA, int offV) {
    const bf16* MQ = (const bf16*)(p.ws + WS_MQ) + (size_t)item * 4096; const bf16* MS = (const bf16*)(p.ws + WS_MS) + (size_t)item * 4096; const bf16* MK = (const bf16*)(p.ws + WS_MK) + (size_t)item * 4096;
    const bf16* MV = (const bf16*)(p.ws + WS_MV) + (size_t)item * 9216;
#pragma unroll
    for (int ks = 0; ks < 2; ++ks) { F.q[ks] = *(const bf16x8_t*)(MQ + offA + 32 * ks); F.s[ks] = *(const bf16x8_t*)(MS + offA + 32 * ks); F.kt[ks] = *(const bf16x8_t*)(MK + offA + 32 * ks); F.vt[ks] = *(const bf16x8_t*)(MV + offV + 32 * ks); }
    F.fl = ((const float*)(p.ws + WS_MFL))[item];
}
__device__ __forceinline__ void ml_seq(const Params& p, LAS unsigned char* lds, int wgi, int wave, int lane) {
    const int u = wgi * 2 + (wave >> 2), wi = wave & 3, h = u / 9, sl = u % 9, g = lane >> 4, c = lane & 15;
    LAS unsigned short* CT = (LAS unsigned short*)(lds + (wave >> 2) * 4096);
    float* HO = (float*)(p.ws + WS_HO); float* HDEN = (float*)(p.ws + WS_HDEN);
    const int offA = (16 * wi + c) * 64 + 8 * g, offV = (16 * sl + c) * 64 + 8 * g;
    *(LAS v2u*)(CT + c * 64 + 16 * wi + 4 * g) = (v2u){0u, 0u};
    pg8::f32x4 Cacc = {0.f, 0.f, 0.f, 0.f};
    __syncthreads();
    MlFrags F0, F1;
    ml_load(F0, p, h, offA, offV);
#define ML_STEP(F, n_) do { const int cur = (n_) & 1; \
        const bf16x8_t c0 = *(const LAS bf16x8_t*)(CT + cur * 1024 + c * 64 + 8 * g), c1 = *(const LAS bf16x8_t*)(CT + cur * 1024 + c * 64 + 32 + 8 * g); \
        pg8::f32x4 num = {0.f, 0.f, 0.f, 0.f}; \
        num = __builtin_amdgcn_mfma_f32_16x16x32_bf16(F.q[0], c0, num, 0, 0, 0); num = __builtin_amdgcn_mfma_f32_16x16x32_bf16(F.q[1], c1, num, 0, 0, 0); \
        num = __builtin_amdgcn_mfma_f32_16x16x32_bf16(F.s[0], F.vt[0], num, 0, 0, 0); num = __builtin_amdgcn_mfma_f32_16x16x32_bf16(F.s[1], F.vt[1], num, 0, 0, 0); \
        Cacc = Cacc * F.fl; \
        Cacc = __builtin_amdgcn_mfma_f32_16x16x32_bf16(F.kt[0], F.vt[0], Cacc, 0, 0, 0); Cacc = __builtin_amdgcn_mfma_f32_16x16x32_bf16(F.kt[1], F.vt[1], Cacc, 0, 0, 0); \
        { v2u w; w.x = pk2(Cacc[0], Cacc[1]); w.y = pk2(Cacc[2], Cacc[3]); *(LAS v2u*)(CT + (cur ^ 1) * 1024 + c * 64 + 16 * wi + 4 * g) = w; } \
        { const size_t tb = (size_t)(n_) * 64 + 16 * wi + 4 * g; \
          if (sl < 8) { _Pragma("unroll") for (int r = 0; r < 4; ++r) HO[(tb + r) * BW + h * 128 + 16 * sl + c] = num[r]; } \
          else if (c == 0) { _Pragma("unroll") for (int r = 0; r < 4; ++r) HDEN[(tb + r) * 4 + h] = num[r]; } } \
        __syncthreads(); } while (0)
    for (int n = 0; n < T / 64; n += 2) {
        ml_load(F1, p, (n + 1) * 4 + h, offA, offV);
        ML_STEP(F0, n);
        if (n + 2 < T / 64) ml_load(F0, p, (n + 2) * 4 + h, offA, offV);
        ML_STEP(F1, n + 1);
    }
#undef ML_STEP
}

__device__ __forceinline__ void mixer_gmlp_item(const Params& p, int l, LAS unsigned char* lds, int item, int tid, int wave, int lane) {
    const int chunk = item >> 2, g = item & 3; const size_t tok0 = (size_t)chunk * 128;
    const bf16* Z = (const bf16*)(p.ws + WS_Z); bf16* BR1 = (bf16*)(p.ws + WS_BR) + (size_t)1 * T * BW;
    const float* ng = p.in[I_GMNG] + l * BW; const float* nb = p.in[I_GMNB] + l * BW;
    const float* wsp = p.in[I_GMWS] + ((size_t)(l * 4 + g) * 128) * 128; const float* bsp = p.in[I_GMBS] + (l * 4 + g) * 128;
    LAS float* vn = (LAS float*)lds;
    for (int r = 0; r < 16; ++r) { const int tk = wave * 16 + r;
        const v4u raw = *(const v4u*)(Z + (tok0 + tk) * ZC + ZC_GMV + 8 * lane); float x[8]; unpack8(raw, x); float s = 0.f;
#pragma unroll
        for (int i = 0; i < 8; ++i) { x[i] = gelu_tanh(x[i]); s += x[i]; }
        const float mean = wave_sum(s) * (1.f / 512.f); float ss = 0.f;
#pragma unroll
        for (int i = 0; i < 8; ++i) { x[i] -= mean; ss += x[i] * x[i]; }
        const float rstd = rsqrtf(wave_sum(ss) * (1.f / 512.f) + LN_EPS);
        if ((lane >> 4) == g) { const int cl = 8 * (lane & 15);
#pragma unroll
            for (int i = 0; i < 8; ++i) vn[tk * 128 + cl + i] = x[i] * rstd * ng[8 * lane + i] + nb[8 * lane + i]; }
    }
    __syncthreads();
    const int t = tid >> 2, cq = tid & 3; float acc[32];
#pragma unroll
    for (int i = 0; i < 32; ++i) acc[i] = 0.f;
    const float* wrow = wsp + (size_t)t * 128;
    for (int s = 0; s <= t; ++s) { const float w = wrow[s]; const LAS float* row = vn + s * 128 + cq * 32;
#pragma unroll
        for (int i4 = 0; i4 < 8; ++i4) { const v4f a = *(const LAS v4f*)(row + 4 * i4); acc[4 * i4] += w * a.x; acc[4 * i4 + 1] += w * a.y; acc[4 * i4 + 2] += w * a.z; acc[4 * i4 + 3] += w * a.w; } }
    const float bias = bsp[t];
#pragma unroll
    for (int i8 = 0; i8 < 4; ++i8) { const v4u raw = *(const v4u*)(Z + (tok0 + t) * ZC + ZC_GMU + g * 128 + cq * 32 + 8 * i8); float u[8]; unpack8(raw, u); float o[8];
#pragma unroll
        for (int i = 0; i < 8; ++i) o[i] = gelu_tanh(u[i]) * (acc[8 * i8 + i] + bias);
        v4u w; w.x = pk2(o[0], o[1]); w.y = pk2(o[2], o[3]); w.z = pk2(o[4], o[5]); w.w = pk2(o[6], o[7]);
        *(v4u*)(BR1 + (tok0 + t) * BW + g * 128 + cq * 32 + 8 * i8) = w; }
    __syncthreads();
}
__device__ __forceinline__ void mixer_sb_item(const Params& p, LAS float* qs  , int item, int lane) {
    const int h = item >> 11, t0 = (item & 2047) * 4;
    const bf16* Z = (const bf16*)(p.ws + WS_Z); bf16* BR0 = (bf16*)(p.ws + WS_BR);
#pragma unroll
    for (int qi = 0; qi < 4; ++qi) { const unsigned w = *(const unsigned*)(Z + (size_t)(t0 + qi) * ZC + ZC_SBQ + h * 128 + 2 * lane);
        qs[qi * 128 + 2 * lane] = bflo(w) * 0.08838834764831845f; qs[qi * 128 + 2 * lane + 1] = bfhi(w) * 0.08838834764831845f; }
    LDS_WAIT(); asm volatile("" ::: "memory");
    float acc[4][2], racc[4];
#pragma unroll
    for (int qi = 0; qi < 4; ++qi) { acc[qi][0] = 0.f; acc[qi][1] = 0.f; racc[qi] = 0.f; }
    for (int base = t0 + 2; base >= 0; base -= 64) {
        const int s = base - lane; const bool vk = s >= 0; const int sc = vk ? s : 0;
        float z[4] = {0.f, 0.f, 0.f, 0.f};
        const bf16* krow = Z + (size_t)sc * ZC + ZC_SBK + h * 128;
#pragma unroll 4
        for (int c = 0; c < 16; ++c) { const v4u raw = *(const v4u*)(krow + 8 * c); float kf[8]; unpack8(raw, kf);
#pragma unroll
            for (int qi = 0; qi < 4; ++qi) { const v4f q0 = *(const LAS v4f*)(qs + qi * 128 + 8 * c), q1 = *(const LAS v4f*)(qs + qi * 128 + 8 * c + 4);
                z[qi] += q0.x * kf[0] + q0.y * kf[1] + q0.z * kf[2] + q0.w * kf[3] + q1.x * kf[4] + q1.y * kf[5] + q1.z * kf[6] + q1.w * kf[7]; } }
        float a[4];
#pragma unroll
        for (int qi = 0; qi < 4; ++qi) { const bool m = vk && (s < t0 + qi); const float sp = m ? softplusf_(z[qi]) : 0.f;
            const float incl = wave_scan_incl(sp); const float tot = __builtin_bit_cast(float, __builtin_amdgcn_readlane(__builtin_bit_cast(int, incl), 63));
            a[qi] = m ? __expf(z[qi] - sp - (racc[qi] + (incl - sp))) : 0.f; racc[qi] += tot; }
#pragma unroll 8
        for (int kl = 0; kl < 64; ++kl) { int sk = base - kl; sk = sk < 0 ? 0 : sk;
            const unsigned w = *(const unsigned*)(Z + (size_t)sk * ZC + ZC_SBV + h * 128 + 2 * lane); const float v0 = bflo(w), v1 = bfhi(w);
#pragma unroll
            for (int qi = 0; qi < 4; ++qi) { const float aw = __builtin_bit_cast(float, __builtin_amdgcn_readlane(__builtin_bit_cast(int, a[qi]), kl)); acc[qi][0] += aw * v0; acc[qi][1] += aw * v1; } }
        if (fminf(fminf(racc[0], racc[1]), fminf(racc[2], racc[3])) > 104.f) break;
    }
#pragma unroll
    for (int qi = 0; qi < 4; ++qi) *(unsigned*)(BR0 + (size_t)(t0 + qi) * BW + h * 128 + 2 * lane) = pk2(acc[qi][0], acc[qi][1]);
}
__device__ __forceinline__ void phase_mixers(const Params& p, int l, LAS unsigned char* lds, int wg, int G, int tid, int wave, int lane, const XcdBarrier& bar) {
#if defined(PROBE_SPLIT)
    if (wg < 8) mixer_gdn_scan(p, lds, wg, tid, wave, lane);
    else if (wg < 12) mixer_mlstm_scan(p, l, lds, wg - 8, tid, wave, lane);
    xcd_barrier(bar);
    { const int w2 = wg, G2 = G;
      for (int it = w2; it < 256; it += G2) mixer_gmlp_item(p, l, lds, it, tid, wave, lane);
      LAS float* qs = (LAS float*)(lds + wave * 2048);
      for (int it = w2 * 8 + wave; it < 4 * 2048; it += G2 * 8) mixer_sb_item(p, qs, it, lane); }
#else
    if (wg < 8) { mixer_gdn_scan(p, lds, wg, tid, wave, lane); return; }
    if (wg < 26) { ml_seq(p, lds, wg - 8, wave, lane); return; }
    const int w2 = wg - 26, G2 = G - 26;
    for (int it = w2; it < 256; it += G2) mixer_gmlp_item(p, l, lds, it, tid, wave, lane);
    LAS float* qs = (LAS float*)(lds + wave * 2048);
    for (int it = w2 * 8 + wave; it < 4 * 2048; it += G2 * 8) mixer_sb_item(p, qs, it, lane);
#endif
}

__device__ __forceinline__ void phase_post(const Params& p, int l, int gw, int NGW, int lane) {
    const bf16* Z = (const bf16*)(p.ws + WS_Z); const float* GO = (const float*)(p.ws + WS_GO); const float* HO = (const float*)(p.ws + WS_HO); const float* HDEN = (const float*)(p.ws + WS_HDEN);
    bf16* BR2 = (bf16*)(p.ws + WS_BR) + (size_t)2 * T * BW; bf16* BR3 = (bf16*)(p.ws + WS_BR) + (size_t)3 * T * BW;
    const float* gng = p.in[I_GDNNG] + l * 128; const float* mng = p.in[I_MLNG] + l * BW;
    for (int t = gw; t < T; t += NGW) {
        {   const v4f a0 = *(const v4f*)(GO + (size_t)t * BW + 8 * lane), a1 = *(const v4f*)(GO + (size_t)t * BW + 8 * lane + 4); float o[8] = {a0.x, a0.y, a0.z, a0.w, a1.x, a1.y, a1.z, a1.w}; float ss = 0.f;
#pragma unroll
            for (int i = 0; i < 8; ++i) ss += o[i] * o[i];
            const float r = rsqrtf(sum16(ss) * (1.f / 128.f) + LN_EPS);
            const v4u graw = *(const v4u*)(Z + (size_t)t * ZC + ZC_GDNG + 8 * lane); float gt[8]; unpack8(graw, gt);
#pragma unroll
            for (int i = 0; i < 8; ++i) o[i] = o[i] * r * gng[(8 * lane + i) & 127] * siluf_(gt[i]);
            v4u w; w.x = pk2(o[0], o[1]); w.y = pk2(o[2], o[3]); w.z = pk2(o[4], o[5]); w.w = pk2(o[6], o[7]); *(v4u*)(BR2 + (size_t)t * BW + 8 * lane) = w; }
        {   const v4f a0 = *(const v4f*)(HO + (size_t)t * BW + 8 * lane), a1 = *(const v4f*)(HO + (size_t)t * BW + 8 * lane + 4); float o[8] = {a0.x, a0.y, a0.z, a0.w, a1.x, a1.y, a1.z, a1.w}; float ss = 0.f;
            const float dn = 1.f / fmaxf(fabsf(HDEN[(size_t)t * 4 + (lane >> 4)]), 1.f);
#pragma unroll
            for (int i = 0; i < 8; ++i) { o[i] *= dn; ss += o[i] * o[i]; }
            const float r = rsqrtf(sum16(ss) * (1.f / 128.f) + LN_EPS);
            const v4u graw = *(const v4u*)(Z + (size_t)t * ZC + ZC_MLO + 8 * lane); float gt[8]; unpack8(graw, gt);
#pragma unroll
            for (int i = 0; i < 8; ++i) o[i] = o[i] * r * mng[8 * lane + i] * sigmoidf_(gt[i]);
            v4u w; w.x = pk2(o[0], o[1]); w.y = pk2(o[2], o[3]); w.z = pk2(o[4], o[5]); w.w = pk2(o[6], o[7]); *(v4u*)(BR3 + (size_t)t * BW + 8 * lane) = w; }
    }
}

__device__ __forceinline__ void ln_row(const float* yrow, const float* g, const float* b, int lane, v4f (&v)[8]) {
    const v4f* yr = (const v4f*)yrow + lane; float s = 0.f;
#pragma unroll
    for (int j = 0; j < 8; ++j) { v[j] = yr[64 * j]; s += (v[j].x + v[j].y) + (v[j].z + v[j].w); }
    const float mean = wave_sum(s) * (1.f / D); float s2 = 0.f;
#pragma unroll
    for (int j = 0; j < 8; ++j) { v[j] = v[j] - mean; s2 += (v[j].x * v[j].x + v[j].y * v[j].y) + (v[j].z * v[j].z + v[j].w * v[j].w); }
    const float rstd = rsqrtf(wave_sum(s2) * (1.f / D) + LN_EPS);
#pragma unroll
    for (int j = 0; j < 8; ++j) { const v4f gg = ((const v4f*)g)[lane + 64 * j], bb = ((const v4f*)b)[lane + 64 * j]; v[j] = v[j] * rstd * gg + bb; }
}
__device__ __forceinline__ void phase_ln1_router(const Params& p, int l, LAS unsigned char* lds, int wg, int G, int wave, int lane) {
    const float* Y = (const float*)(p.ws + WS_Y); float* X1 = (float*)(p.ws + WS_X1); bf16* X1B = (bf16*)(p.ws + WS_X1B); int* LIST = (int*)(p.ws + WS_LIST); float* WL = (float*)(p.ws + WS_WL); unsigned* SLOT = (unsigned*)(p.ws + WS_SLOT);
    unsigned* cnt = (unsigned*)(p.ws + WS_CTL) + CW_CNT + l * 4096;
    const float* g1 = p.in[I_LN1G] + (size_t)l * D; const float* b1 = p.in[I_LN1B] + (size_t)l * D;
    const float* wr = p.in[I_WR] + (size_t)l * D * NE; const float rbias = p.in[I_RB][l * NE + lane];
    LAS float* xt = (LAS float*)lds;
    LAS float* part = (LAS float*)(lds + 65536);
    for (int tl = wg; tl < T / 8; tl += G) {
        const size_t m = (size_t)tl * 8 + wave;
        {   v4f v[8]; ln_row(Y + m * D, g1, b1, lane, v);
            v4f* xo = (v4f*)(X1 + m * D) + lane; v2u* xb = (v2u*)(X1B + m * D) + lane;
#pragma unroll
            for (int j = 0; j < 8; ++j) { xo[64 * j] = v[j]; v2u o; o.x = pk2(v[j].x, v[j].y); o.y = pk2(v[j].z, v[j].w); xb[64 * j] = o; *(LAS v4f*)(xt + wave * D + 4 * lane + 256 * j) = v[j]; } }
        __syncthreads();
        {   float acc[8];
#pragma unroll
            for (int r = 0; r < 8; ++r) acc[r] = 0.f;
#pragma unroll 2
            for (int d4 = 0; d4 < 64; ++d4) { const int d = wave * 256 + 4 * d4;
                const float w0 = wr[(size_t)(d + 0) * NE + lane], w1 = wr[(size_t)(d + 1) * NE + lane], w2 = wr[(size_t)(d + 2) * NE + lane], w3 = wr[(size_t)(d + 3) * NE + lane];
#pragma unroll
                for (int r = 0; r < 8; ++r) { const v4f xv = *(const LAS v4f*)(xt + r * D + d); acc[r] += xv.x * w0 + xv.y * w1 + xv.z * w2 + xv.w * w3; } }
#pragma unroll
            for (int r = 0; r < 8; ++r) part[(wave * 8 + r) * 64 + lane] = acc[r]; }
        __syncthreads();
        {   float logit = 0.f;
#pragma unroll
            for (int w = 0; w < 8; ++w) logit += part[(w * 8 + wave) * 64 + lane];
            const float s = sigmoidf_(logit), biased = s + rbias;
            const float m1 = max8(biased); const float li = (float)(lane & 7);
            const float first = min8(biased == m1 ? li : 8.f);
            const float m2 = max8(li == first ? -INFINITY : biased);
            const float gs = m1 + m2; const int myg = lane >> 3; int grank = 0;
#pragma unroll
            for (int g2 = 0; g2 < 8; ++g2) { const float o = __builtin_bit_cast(float, __builtin_amdgcn_readlane(__builtin_bit_cast(int, gs), g2 * 8)); grank += (o > gs || (o == gs && g2 < myg)) ? 1 : 0; }
            const float masked = grank < 4 ? biased : -INFINITY; int rank = 0;
#pragma unroll
            for (int e2 = 0; e2 < 64; ++e2) { const float o = __builtin_bit_cast(float, __builtin_amdgcn_readlane(__builtin_bit_cast(int, masked), e2)); rank += (o > masked || (o == masked && e2 < lane)) ? 1 : 0; }
            const float wsel = rank < 6 ? s : 0.f; const float tot = wave_sum(wsel);
            if (rank < 6) { const unsigned pos = __hip_atomic_fetch_add(cnt + 64 * lane, 1u, __ATOMIC_RELAXED, __HIP_MEMORY_SCOPE_AGENT);
                LIST[lane * T + pos] = (int)m; WL[lane * T + pos] = wsel / tot * 2.5f; SLOT[m * 8 + rank] = ((unsigned)lane << 16) | pos; } }
        __syncthreads();
    }
}
__device__ __forceinline__ void phase_combine_ln2(const Params& p, int l, float* dst, int gw, int NGW, int lane) {
    const float* X1 = (const float*)(p.ws + WS_X1); const bf16* YE = (const bf16*)(p.ws + WS_YEXP); const unsigned* SLOT = (const unsigned*)(p.ws + WS_SLOT);
    const unsigned* cnt = (const unsigned*)(p.ws + WS_CTL) + CW_CNT + l * 4096;
    const float* g2 = p.in[I_LN2G] + (size_t)l * D; const float* b2 = p.in[I_LN2B] + (size_t)l * D;
    const int tiles = ((int)cnt[64 * lane] + 255) >> 8; const float incl = wave_scan_incl((float)tiles);
    const int toff = (int)incl - tiles;
    const int tsh = __builtin_amdgcn_readlane((int)incl, 63);
    for (int m = gw; m < T; m += NGW) {
        v4f v[8]; const v4f* xr = (const v4f*)(X1 + (size_t)m * D) + lane;
#pragma unroll
        for (int j = 0; j < 8; ++j) v[j] = xr[64 * j] * ALPHA;
#pragma unroll
        for (int k = 0; k < 7; ++k) { size_t row;
            if (k == 0) row = (size_t)tsh * 256 + m;
            else { const unsigned s = __builtin_amdgcn_readfirstlane(SLOT[(size_t)m * 8 + (k - 1)]); const int e = (int)(s >> 16); row = (size_t)__builtin_amdgcn_readlane(toff, e) * 256 + (s & 0xffffu); }
            const v2u* yr = (const v2u*)(YE + row * D) + lane;
#pragma unroll
            for (int j = 0; j < 8; ++j) { const v2u y = yr[64 * j]; v[j].x += bflo(y.x); v[j].y += bfhi(y.x); v[j].z += bflo(y.y); v[j].w += bfhi(y.y); } }
        float s = 0.f;
#pragma unroll
        for (int j = 0; j < 8; ++j) s += (v[j].x + v[j].y) + (v[j].z + v[j].w);
        const float mean = wave_sum(s) * (1.f / D); float s2 = 0.f;
#pragma unroll
        for (int j = 0; j < 8; ++j) { v[j] = v[j] - mean; s2 += (v[j].x * v[j].x + v[j].y * v[j].y) + (v[j].z * v[j].z + v[j].w * v[j].w); }
        const float rstd = rsqrtf(wave_sum(s2) * (1.f / D) + LN_EPS);
        v4f* xo = (v4f*)(dst + (size_t)m * D) + lane;
#pragma unroll
        for (int j = 0; j < 8; ++j) { const v4f gg = ((const v4f*)g2)[lane + 64 * j], bb = ((const v4f*)b2)[lane + 64 * j]; xo[64 * j] = v[j] * rstd * gg + bb; }
    }
}

constexpr int NPH = 11;
template <int l>
__device__ __forceinline__ void run_layer(const Params& p, LAS unsigned char* lds, const XcdBarrier& bar, int tid, int lane, int wave, int G, int wg, int gw, int NGW) {
    unsigned char* ws = p.ws;
    {
        const float* xin = (l == 0) ? p.in[I_X] : (const float*)(ws + WS_XCUR);
        float* xout = (l == NL - 1) ? p.out : (float*)(ws + WS_XCUR);
#ifndef PROBE_DUP
#define PROBE_DUP (-1)
#endif
#define REP(k) for (int _r = 0; _r < (PROBE_DUP == (k) ? 2 : 1); ++_r)
#ifndef PH_MASK
#define PH_MASK 0x7ff
#endif
#define RUN(k) (((PH_MASK >> (k)) & 1) && p.ph_lo <= l * NPH + (k) && l * NPH + (k) < p.ph_hi)
#define SEAM(k) do { if (l * NPH + (k) + 1 < p.ph_hi) xcd_barrier(bar); } while (0)
        if (RUN(0)) { REP(0) { phase_convert(p, l, lds, gw, NGW, wave, lane); phase_xprep(p, l, xin, lds, gw, NGW, tid, lane); } SEAM(0); }
        if (RUN(1)) { REP(1) { pg8::Gemm g{(const bf16*)(ws + WS_XB), (const bf16*)(ws + WS_WIN), T, ZC, D, D, D}; pg8::StaticOrder S; S.init(T, ZC, G, wg);
            pg8::EpiBf16<0> E{(bf16*)(ws + WS_Z), ZC, nullptr, 0, 0, 1.f};
            pg8::gemm_phase<pg8::EpiBf16<0>, pg8::StaticOrder, true, true>(lds, g, S, E); } SEAM(1); }
        if (RUN(2)) { REP(2) { phase_gdn_prep(p, l, gw, NGW, lane); for (int it = wg; it < 512; it += G) ml_pre_item(p, l, lds, it, tid, wave, lane); } SEAM(2); }
        if (RUN(3)) { REP(3) { phase_mixers(p, l, lds, wg, G, tid, wave, lane, bar); } SEAM(3); }
        if (RUN(4)) { REP(4) { phase_post(p, l, gw, NGW, lane); } SEAM(4); }
        if (RUN(5)) { REP(5) { pg8::Gemm g{(const bf16*)(ws + WS_BR), (const bf16*)(ws + WS_WBR), 4 * T, 4 * D, BW, BW, BW}; MergeOrder S{G, wg};
            EpiMerge E{(const bf16*)(ws + WS_Z), (float*)(ws + WS_MTMP), (bf16*)(ws + WS_MSUM)};
            pg8::gemm_phase<EpiMerge, MergeOrder, true, true>(lds, g, S, E); } SEAM(5); }
        if (RUN(6)) { REP(6) { pg8::Gemm g{(const bf16*)(ws + WS_MSUM), (const bf16*)(ws + WS_WOUT), T, D, D, D, D}; pg8::StaticOrder S; S.init(T, D, G, wg);
            EpiResid E{xin, (float*)(ws + WS_Y)};
            pg8::gemm_phase<EpiResid, pg8::StaticOrder, true, true>(lds, g, S, E); } SEAM(6); }
        if (RUN(7)) { REP(7) { phase_ln1_router(p, l, lds, wg, G, wave, lane); } SEAM(7); }
        if (RUN(8)) { REP(8) { const unsigned* cnt = (const unsigned*)(ws + WS_CTL) + CW_CNT + l * 4096; MoeTab M(lds); moe_tables(M, cnt, tid, lane, wave);
            UpOrder S{M, 0}; S.n = up_order_build(M, (const int*)(ws + WS_LIST), (const float*)(ws + WS_WL), wg, G, tid);
            pg8::Gemm g{(const bf16*)(ws + WS_X1B), (const bf16*)(ws + WS_WUP), T, NEX * 1024, D, D, D};
            EpiGluSparse E{(LAS const float*)M.wt, (bf16*)(ws + WS_HB)};
            pg8::gemm_phase_gather<EpiGluSparse, UpOrder>(lds, g, S, E); } SEAM(8); }
        if (RUN(9)) { REP(9) { const unsigned* cnt = (const unsigned*)(ws + WS_CTL) + CW_CNT + l * 4096; MoeTab M(lds); moe_tables(M, cnt, tid, lane, wave);
            DownOrder S{M, G, wg, 8 * M.t[65]};
            pg8::Gemm g{(const bf16*)(ws + WS_HB), (const bf16*)(ws + WS_WDN), HROWS, NEX * D, ED, ED, ED};
            EpiYexp E{(bf16*)(ws + WS_YEXP)};
            pg8::gemm_phase<EpiYexp, DownOrder, true, true>(lds, g, S, E); } SEAM(9); }
        if (RUN(10)) { REP(10) { phase_combine_ln2(p, l, xout, gw, NGW, lane); } SEAM(10); }
#undef RUN
#undef SEAM
    }
}
__global__ void __launch_bounds__(512, 2) fwd_kernel(Params p) {
    extern __shared__ __attribute__((aligned(16))) unsigned char lds_raw[];
    LAS unsigned char* lds = (LAS unsigned char*)lds_raw;
    const int tid = threadIdx.x, lane = tid & 63, wave = __builtin_amdgcn_readfirstlane(tid >> 6);
    const int G = gridDim.x, wg = blockIdx.x, gw = wg * 8 + wave, NGW = G * 8;
    volatile LAS unsigned* MISC = (volatile LAS unsigned*)(lds + MISC_OFF);
    if (tid < 32) MISC[tid] = 0u;
    __syncthreads();
    unsigned* ctl = (unsigned*)(p.ws + WS_CTL);
    const bool multi = (p.ph_hi - p.ph_lo) > 1;
    XcdBarrier bar; bar.bar = ctl + CW_BAR; bar.x = 0; bar.st = nullptr;
    if (multi) bar = xcd_barrier_post(ctl + CW_BAR, MISC + 8);
    run_layer<0>(p, lds, bar, tid, lane, wave, G, wg, gw, NGW);
    run_layer<1>(p, lds, bar, tid, lane, wave, G, wg, gw, NGW);
}

#ifndef MK_MULTI_LAUNCH
#define MK_MULTI_LAUNCH 0
#endif
extern "C" void kernel_launch(void* const* d_in, const int* in_sizes, int n_in, void* d_out, int out_size, void* d_ws, size_t ws_size, hipStream_t stream) {
    static int grid = 0;
    if (grid == 0) {
        if (n_in != 27 || out_size != T * D || ws_size < WS_END) { fprintf(stderr, "kernel_launch: unexpected shapes (n_in %d out %d ws %zu need %zu)\n", n_in, out_size, ws_size, (size_t)WS_END); grid = -1; return; }
        int dev = 0, cus = 0, per_cu = 0;
        if (hipGetDevice(&dev) != hipSuccess || hipDeviceGetAttribute(&cus, hipDeviceAttributeMultiprocessorCount, dev) != hipSuccess) { grid = -1; return; }
        if (hipFuncSetAttribute((const void*)fwd_kernel, hipFuncAttributeMaxDynamicSharedMemorySize, LDS_BYTES) != hipSuccess) { fprintf(stderr, "kernel_launch: hipFuncSetAttribute failed\n"); grid = -1; return; }
        if (hipOccupancyMaxActiveBlocksPerMultiprocessor(&per_cu, (const void*)fwd_kernel, 512, LDS_BYTES) != hipSuccess || per_cu < 1) { fprintf(stderr, "kernel_launch: occupancy query says %d\n", per_cu); }
        (void)hipGetLastError();
        grid = cus;
    }
    if (grid < 0) return;
    (void)hipMemsetAsync((char*)d_ws + WS_CTL, 0, CTL_ZERO_BYTES, stream);
    Params p{};
    for (int i = 0; i < 27; ++i) p.in[i] = (const float*)d_in[i];
    p.out = (float*)d_out; p.ws = (unsigned char*)d_ws;
#if MK_MULTI_LAUNCH
    for (int ph = 0; ph < NL * NPH; ++ph) { p.ph_lo = ph; p.ph_hi = ph + 1; hipLaunchKernelGGL(fwd_kernel, dim3(grid), dim3(512), LDS_BYTES, stream, p); }
#else
    p.ph_lo = 0; p.ph_hi = NL * NPH; hipLaunchKernelGGL(fwd_kernel, dim3(grid), dim3(512), LDS_BYTES, stream, p);
#endif
}
```

```cpp
#include <hip/hip_runtime.h>
#include <cstdio>
#include <cstdint>
namespace pg8 {
#define PG8_LAS __attribute__((address_space(3)))
typedef unsigned short bf16_t;
typedef short bf16x8 __attribute__((ext_vector_type(8)));
typedef float f32x4 __attribute__((ext_vector_type(4)));
typedef unsigned u32x4 __attribute__((ext_vector_type(4)));
constexpr int BM = 256, BK = 64, HALF = 128, HTB = HALF * BK * 2  , STAGE_BYTES = 8 * HTB, NXCD = 8, WGM = 8;

__host__ __device__ __forceinline__ int lds_byte(int r, int c) { const int st = (r >> 4) * 2 + (c >> 5), rr = r & 15, cc = c & 31, ob = rr * 64 + cc * 2; return st * 1024 + (ob ^ (((ob >> 9) & 1) << 5)); }
__host__ __device__ __forceinline__ void stage_rc(int b, int& R, int& C) { const int st = b / 1024, sb = b % 1024, swz = sb ^ (((sb >> 9) & 1) << 5); R = (st >> 1) * 16 + swz / 64; C = (st & 1) * 32 + (swz % 64) / 2; }
__host__ __device__ __forceinline__ int perm32(int rho) { const int n = rho >> 4, i = rho & 15; return 8 * (i >> 2) + 4 * n + (i & 3); }

struct Unit { int pm, pn, aux; };
struct Gemm { const bf16_t* A; const bf16_t* Bt; int M, N, K, lda, ldb; };

struct StaticOrder {
    int nM, nN, nwg, G, c;
    __host__ __device__ void init(int M, int N, int G_, int c_) { nM = M / BM; nN = N / BM; nwg = nM * nN; G = G_; c = c_; }
    __host__ __device__ bool next(int i, Unit& u) const {
        const long L = (long)i * G + c; if (L >= nwg) return false;
        int wgid = (int)L; { const int q = nwg / NXCD, r = nwg % NXCD, xcd = wgid % NXCD, off = wgid / NXCD; wgid = (xcd < r ? xcd * (q + 1) : r * (q + 1) + (xcd - r) * q) + off; }
        const int nig = WGM * nN, gid = wgid / nig, fm = gid * WGM, gsz = (nM - fm) < WGM ? (nM - fm) : WGM;
        u.pm = fm + ((wgid % nig) % gsz); u.pn = (wgid % nig) / gsz; return true;
    }
    __device__ __forceinline__ void a_ready(const Unit&) const {}
    __device__ __forceinline__ void done(const Unit&) const {}
};

__device__ __forceinline__ unsigned cvt_pk_bf16(float lo, float hi) { unsigned r; asm volatile("v_cvt_pk_bf16_f32 %0, %1, %2" : "=v"(r) : "v"(lo), "v"(hi)); return r; }
typedef float f32x2 __attribute__((ext_vector_type(2)));
__device__ __forceinline__ f32x2 gelu_pk(f32x2 v) {
    const f32x2 av = __builtin_elementwise_abs(v), d = av * 0.2316418882f + 1.0f;
    f32x2 t; t.x = __builtin_amdgcn_rcpf(d.x); t.y = __builtin_amdgcn_rcpf(d.y);
    f32x2 q = t * 0.5307027145f + (-0.7265760135f); q = q * t + 0.7107068705f; q = q * t + (-0.142248368f); q = q * t + 0.127414796f; q = q * t;
    const f32x2 s = (v * v) * (-0.72134752044f);
    f32x2 e; e.x = __builtin_amdgcn_exp2f(s.x); e.y = __builtin_amdgcn_exp2f(s.y);
    const f32x2 m = v * (q * e), r = v - m;
    f32x2 o; o.x = v.x < 0.f ? m.x : r.x; o.y = v.y < 0.f ? m.y : r.y; return o;
}

template <int ACT  > struct EpiBf16 {
    static constexpr bool PERM = true, AFTER_DRAIN = false; static_assert(ACT == 0 || ACT == 1, "EpiBf16: ACT is 0 (none) or 1 (gelu_pk)");
    bf16_t* O; int ldc; const float* bias; int split_cols; size_t split_stride; float scale0;
    __device__ __forceinline__ void operator()(const f32x4 (&acc)[2][2][4][2], const Unit& u, int wr, int wc, int fr, int fq) const {
        const int row0 = u.pm * BM + wr * 64 + fr; int colt = u.pn * BM; bf16_t* base = O;
        float sc = 1.f; if (split_cols) { const int t = colt / split_cols; base += (size_t)t * split_stride; colt -= t * split_cols; if (t == 0) sc = scale0; }
        const int col0 = colt + wc * 32 + 8 * fq, bcol0 = u.pn * BM + wc * 32 + 8 * fq;
        f32x4 bv[2][2];
#pragma unroll
        for (int bj = 0; bj < 2; ++bj)
#pragma unroll
            for (int n = 0; n < 2; ++n) bv[bj][n] = bias ? *(const f32x4*)(bias + bcol0 + bj * HALF + 4 * n) : (f32x4){0.f, 0.f, 0.f, 0.f};
#pragma unroll
        for (int ai = 0; ai < 2; ++ai)
#pragma unroll
            for (int m = 0; m < 4; ++m) { bf16_t* rowp = base + (size_t)(row0 + ai * HALF + m * 16) * ldc + col0;
#pragma unroll
                for (int bj = 0; bj < 2; ++bj) { f32x4 v0 = acc[ai][bj][m][0] + bv[bj][0], v1 = acc[ai][bj][m][1] + bv[bj][1];
                    if (ACT == 1) { f32x2 a = gelu_pk((f32x2){v0[0], v0[1]}), b = gelu_pk((f32x2){v0[2], v0[3]}), c = gelu_pk((f32x2){v1[0], v1[1]}), d = gelu_pk((f32x2){v1[2], v1[3]});
                        v0 = (f32x4){a.x, a.y, b.x, b.y}; v1 = (f32x4){c.x, c.y, d.x, d.y}; }
                    v0 = v0 * sc; v1 = v1 * sc; u32x4 w; w.x = cvt_pk_bf16(v0[0], v0[1]); w.y = cvt_pk_bf16(v0[2], v0[3]); w.z = cvt_pk_bf16(v1[0], v1[1]); w.w = cvt_pk_bf16(v1[2], v1[3]);
                    *(u32x4*)(rowp + bj * HALF) = w; } }
    }
};

template <class Epi, class Sched, bool ALIGN_EPI = false, bool SP2 = false>
__device__ __forceinline__ void gemm_phase(PG8_LAS unsigned char* lds, const Gemm g, const Sched& S, const Epi& E) {
    const int tid = threadIdx.x, wid = __builtin_amdgcn_readfirstlane(tid >> 6), lane = tid & 63, wr = wid >> 2, wc = wid & 3, fr = lane & 15, fq = lane >> 4;
    const int K = g.K, nt = K / BK;
    unsigned voffA[2], voffB[2];
#pragma unroll
    for (int i = 0; i < 2; ++i) { int R, C; stage_rc(tid * 16 + i * 8192, R, C); const int Rb = Epi::PERM ? ((R & ~31) + perm32(R & 31)) : R;
        voffA[i] = (unsigned)(R * g.lda + C) * 2u; voffB[i] = (unsigned)(Rb * g.ldb + C) * 2u; }
    const size_t kstep = (size_t)(BK * 2);
    const size_t hstepA = (size_t)HALF * g.lda * 2, hstepB = (size_t)HALF * g.ldb * 2;
    const size_t tstepA = 2 * hstepA, tstepB = 2 * hstepB;
    const unsigned ldsw = (unsigned)wid * 1024u;
    const int aoff = lds_byte(wr * 64 + fr, fq * 8), boff = lds_byte(wc * 32 + fr, fq * 8);
#define PG8_SA(b, h) (((b) * 2 + (h)) * HTB)
#define PG8_SB(b, h) ((4 + (b) * 2 + (h)) * HTB)
#define PG8_STAGE(bufoff, gbase, voff) do { _Pragma("unroll") for (int _i = 0; _i < 2; ++_i) \
        __builtin_amdgcn_global_load_lds((const unsigned*)((const char*)(gbase) + (voff)[_i]), (PG8_LAS unsigned*)(lds + (bufoff) + ldsw + _i * 8192), 16, 0, 0); } while (0)
#define PG8_LDA(dst, b, h) do { _Pragma("unroll") for (int m = 0; m < 4; ++m) _Pragma("unroll") for (int k = 0; k < 2; ++k) dst[m][k] = *(const PG8_LAS bf16x8*)(lds + PG8_SA(b, h) + aoff + m * 2048 + k * 1024); } while (0)
#define PG8_LDB(dst, b, h) do { _Pragma("unroll") for (int n = 0; n < 2; ++n) _Pragma("unroll") for (int k = 0; k < 2; ++k) dst[n][k] = *(const PG8_LAS bf16x8*)(lds + PG8_SB(b, h) + boff + n * 2048 + k * 1024); } while (0)
#define PG8_MMA(ai, bj, At, Bt) do { __builtin_amdgcn_s_setprio(1); _Pragma("unroll") for (int m = 0; m < 4; ++m) _Pragma("unroll") for (int n = 0; n < 2; ++n) _Pragma("unroll") for (int k = 0; k < 2; ++k) \
        acc[ai][bj][m][n] = __builtin_amdgcn_mfma_f32_16x16x32_bf16(Bt[n][k], At[m][k], acc[ai][bj][m][n], 0, 0, 0); __builtin_amdgcn_s_setprio(0); } while (0)
#define PG8_WAIT_V(n) asm volatile("s_waitcnt vmcnt(" #n ")" ::: "memory")
#define PG8_WAIT_L(n) asm volatile("s_waitcnt lgkmcnt(" #n ")" ::: "memory")
#define PG8_BAR __builtin_amdgcn_s_barrier()
#define PG8_SCHED __builtin_amdgcn_sched_barrier(0)
    Unit cur, nxt; int ui = 0;
    if (!S.next(0, cur)) return;
    f32x4 acc[2][2][4][2];
#pragma unroll
    for (int a = 0; a < 2; ++a)
#pragma unroll
        for (int b = 0; b < 2; ++b)
#pragma unroll
            for (int m = 0; m < 4; ++m)
#pragma unroll
                for (int n = 0; n < 2; ++n) acc[a][b][m][n] = (f32x4){0.f, 0.f, 0.f, 0.f};
    bf16x8 At[4][2], B0[2][2], B1[2][2];
    const char* cA = (const char*)g.A + (size_t)cur.pm * tstepA; const char* cB = (const char*)g.Bt + (size_t)cur.pn * tstepB;
    S.a_ready(cur);
    if constexpr (SP2) {
        PG8_STAGE(PG8_SB(0, 0), cB, voffB); PG8_STAGE(PG8_SB(0, 1), cB + hstepB, voffB); PG8_STAGE(PG8_SA(0, 0), cA, voffA); PG8_STAGE(PG8_SA(0, 1), cA + hstepA, voffA);
        if (wr == 1) PG8_BAR;
        PG8_WAIT_V(2); PG8_BAR;
        PG8_STAGE(PG8_SB(1, 0), cB + kstep, voffB); PG8_STAGE(PG8_SA(1, 0), cA + kstep, voffA); PG8_STAGE(PG8_SB(1, 1), cB + hstepB + kstep, voffB);
        PG8_WAIT_V(6); PG8_BAR;
    } else {
        PG8_STAGE(PG8_SB(0, 0), cB, voffB); PG8_STAGE(PG8_SA(0, 0), cA, voffA); PG8_STAGE(PG8_SB(0, 1), cB + hstepB, voffB); PG8_STAGE(PG8_SA(0, 1), cA + hstepA, voffA);
        if (wr == 1) PG8_BAR;
        PG8_WAIT_V(4); PG8_BAR;
        PG8_STAGE(PG8_SB(1, 0), cB + kstep, voffB); PG8_STAGE(PG8_SA(1, 0), cA + kstep, voffA); PG8_STAGE(PG8_SB(1, 1), cB + hstepB + kstep, voffB);
        PG8_WAIT_V(6); PG8_BAR;
    }
    for (;;) {
        const bool has_next = S.next(ui + 1, nxt);
        const char* nA = has_next ? (const char*)g.A + (size_t)nxt.pm * tstepA : cA; const char* nB = has_next ? (const char*)g.Bt + (size_t)nxt.pn * tstepB : cB;
        for (int t = 0; t < nt; t += 2) {
            const bool last = (t == nt - 2);
            const char* a1 = cA + (size_t)(t + 1) * kstep;
            const char* a2 = last ? nA : cA + (size_t)(t + 2) * kstep; const char* b2 = last ? nB : cB + (size_t)(t + 2) * kstep;
            const char* a3 = a2 + kstep; const char* b3 = b2 + kstep;
            if (last && has_next) S.a_ready(nxt);
            if constexpr (SP2) {
            PG8_LDB(B0, 0, 0); PG8_LDB(B1, 0, 1); PG8_SCHED; PG8_LDA(At, 0, 0); PG8_STAGE(PG8_SA(1, 1), a1 + hstepA, voffA);
            PG8_WAIT_V(8); PG8_WAIT_L(0); PG8_BAR; PG8_MMA(0, 0, At, B0); PG8_MMA(0, 1, At, B1); PG8_BAR; PG8_SCHED;
            PG8_LDA(At, 0, 1); PG8_STAGE(PG8_SB(0, 0), b2, voffB); PG8_STAGE(PG8_SB(0, 1), b2 + hstepB, voffB); PG8_STAGE(PG8_SA(0, 0), a2, voffA);
            PG8_WAIT_V(8); PG8_WAIT_L(0); PG8_BAR; PG8_MMA(1, 0, At, B0); PG8_MMA(1, 1, At, B1); PG8_BAR; PG8_SCHED;
            PG8_LDB(B0, 1, 0); PG8_LDB(B1, 1, 1); PG8_SCHED; PG8_LDA(At, 1, 0); PG8_STAGE(PG8_SA(0, 1), a2 + hstepA, voffA);
            PG8_WAIT_V(8); PG8_WAIT_L(0); PG8_BAR; PG8_MMA(0, 0, At, B0); PG8_MMA(0, 1, At, B1); PG8_BAR; PG8_SCHED;
            PG8_LDA(At, 1, 1); PG8_STAGE(PG8_SB(1, 0), b3, voffB); PG8_STAGE(PG8_SB(1, 1), b3 + hstepB, voffB); PG8_STAGE(PG8_SA(1, 0), a3, voffA);
            PG8_WAIT_V(8); PG8_WAIT_L(0); PG8_BAR; PG8_MMA(1, 0, At, B0); PG8_MMA(1, 1, At, B1); PG8_BAR; PG8_SCHED;
            } else {
            PG8_LDB(B0, 0, 0); PG8_SCHED; PG8_LDA(At, 0, 0); PG8_STAGE(PG8_SA(1, 1), a1 + hstepA, voffA);
            PG8_WAIT_L(8); PG8_BAR; PG8_WAIT_L(0); PG8_MMA(0, 0, At, B0); PG8_BAR; PG8_SCHED;
            PG8_LDB(B1, 0, 1); PG8_STAGE(PG8_SB(0, 0), b2, voffB);
            PG8_BAR; PG8_WAIT_L(0); PG8_MMA(0, 1, At, B1); PG8_BAR;
            PG8_LDA(At, 0, 1); PG8_STAGE(PG8_SA(0, 0), a2, voffA);
            PG8_BAR; PG8_WAIT_L(0); PG8_MMA(1, 0, At, B0); PG8_BAR; PG8_SCHED;
            PG8_STAGE(PG8_SB(0, 1), b2 + hstepB, voffB);
            PG8_WAIT_V(6); PG8_BAR; PG8_MMA(1, 1, At, B1); PG8_BAR;
            PG8_LDB(B0, 1, 0); PG8_SCHED; PG8_LDA(At, 1, 0); PG8_STAGE(PG8_SA(0, 1), a2 + hstepA, voffA);
            PG8_WAIT_L(8); PG8_BAR; PG8_WAIT_L(0); PG8_MMA(0, 0, At, B0); PG8_BAR; PG8_SCHED;
            PG8_LDB(B1, 1, 1); PG8_STAGE(PG8_SB(1, 0), b3, voffB);
            PG8_BAR; PG8_WAIT_L(0); PG8_MMA(0, 1, At, B1); PG8_BAR;
            PG8_LDA(At, 1, 1); PG8_STAGE(PG8_SA(1, 0), a3, voffA);
            PG8_BAR; PG8_WAIT_L(0); PG8_MMA(1, 0, At, B0); PG8_BAR; PG8_SCHED;
            PG8_STAGE(PG8_SB(1, 1), b3 + hstepB, voffB);
            PG8_WAIT_V(6); PG8_BAR; PG8_MMA(1, 1, At, B1); PG8_BAR;
            }
        }
        if constexpr (ALIGN_EPI) { if (wr == 0) PG8_BAR; }
        if constexpr (!Epi::AFTER_DRAIN) { E(acc, cur, wr, wc, fr, fq); S.done(cur); }
        if (!has_next) break;
#pragma unroll
        for (int a = 0; a < 2; ++a)
#pragma unroll
            for (int b = 0; b < 2; ++b)
#pragma unroll
                for (int m = 0; m < 4; ++m)
#pragma unroll
                    for (int n = 0; n < 2; ++n) acc[a][b][m][n] = (f32x4){0.f, 0.f, 0.f, 0.f};
        cur = nxt; cA = nA; cB = nB; ++ui;
        if constexpr (ALIGN_EPI) { if (wr == 1) PG8_BAR; }
    }
    PG8_WAIT_V(0);
    if constexpr (!ALIGN_EPI) { if (wr == 0) PG8_BAR; }
    PG8_BAR;
    if constexpr (Epi::AFTER_DRAIN) { E.fused(acc, cur, wr, wc, fr, fq, lds, wid, lane); S.done(cur); }
#undef PG8_SA
#undef PG8_SB
#undef PG8_STAGE
#undef PG8_LDA
#undef PG8_LDB
#undef PG8_MMA
#undef PG8_WAIT_V
#undef PG8_WAIT_L
#undef PG8_BAR
#undef PG8_SCHED
}
template <class Epi, class Sched>
__device__ __forceinline__ void gemm_phase_gather(PG8_LAS unsigned char* lds, const Gemm g, const Sched& S, const Epi& E) {
    const int tid = threadIdx.x, wid = __builtin_amdgcn_readfirstlane(tid >> 6), lane = tid & 63, wr = wid >> 2, wc = wid & 3, fr = lane & 15, fq = lane >> 4;
    const int K = g.K, nt = K / BK;
    unsigned voffB[2]; int RA[2], CA[2];
#pragma unroll
    for (int i = 0; i < 2; ++i) { int R, C; stage_rc(tid * 16 + i * 8192, R, C); const int Rb = Epi::PERM ? ((R & ~31) + perm32(R & 31)) : R;
        RA[i] = R; CA[i] = C; voffB[i] = (unsigned)(Rb * g.ldb + C) * 2u; }
    const size_t kstep = (size_t)(BK * 2);
    const size_t hstepB = (size_t)HALF * g.ldb * 2, tstepB = 2 * hstepB;
    const unsigned ldsw = (unsigned)wid * 1024u;
    const int aoff = lds_byte(wr * 64 + fr, fq * 8), boff = lds_byte(wc * 32 + fr, fq * 8);
#define PG8_SA(b, h) (((b) * 2 + (h)) * HTB)
#define PG8_SB(b, h) ((4 + (b) * 2 + (h)) * HTB)
#define PG8_STAGE(bufoff, gbase, voff) do { _Pragma("unroll") for (int _i = 0; _i < 2; ++_i) \
        __builtin_amdgcn_global_load_lds((const unsigned*)((const char*)(gbase) + (voff)[_i]), (PG8_LAS unsigned*)(lds + (bufoff) + ldsw + _i * 8192), 16, 0, 0); } while (0)
#define PG8_LDA(dst, b, h) do { _Pragma("unroll") for (int m = 0; m < 4; ++m) _Pragma("unroll") for (int k = 0; k < 2; ++k) dst[m][k] = *(const PG8_LAS bf16x8*)(lds + PG8_SA(b, h) + aoff + m * 2048 + k * 1024); } while (0)
#define PG8_LDB(dst, b, h) do { _Pragma("unroll") for (int n = 0; n < 2; ++n) _Pragma("unroll") for (int k = 0; k < 2; ++k) dst[n][k] = *(const PG8_LAS bf16x8*)(lds + PG8_SB(b, h) + boff + n * 2048 + k * 1024); } while (0)
#define PG8_MMA(ai, bj, At, Bt) do { __builtin_amdgcn_s_setprio(1); _Pragma("unroll") for (int m = 0; m < 4; ++m) _Pragma("unroll") for (int n = 0; n < 2; ++n) _Pragma("unroll") for (int k = 0; k < 2; ++k) \
        acc[ai][bj][m][n] = __builtin_amdgcn_mfma_f32_16x16x32_bf16(Bt[n][k], At[m][k], acc[ai][bj][m][n], 0, 0, 0); __builtin_amdgcn_s_setprio(0); } while (0)
#define PG8_WAIT_V(n) asm volatile("s_waitcnt vmcnt(" #n ")" ::: "memory")
#define PG8_WAIT_L(n) asm volatile("s_waitcnt lgkmcnt(" #n ")" ::: "memory")
#define PG8_BAR __builtin_amdgcn_s_barrier()
#define PG8_SCHED __builtin_amdgcn_sched_barrier(0)
#define PG8_ROWS(dst, ui_) do { _Pragma("unroll") for (int _h = 0; _h < 2; ++_h) _Pragma("unroll") for (int _i = 0; _i < 2; ++_i) \
        dst[_h][_i] = (unsigned)S.row_token((ui_), _h * HALF + RA[_i]) * (unsigned)(g.lda * 2) + (unsigned)(CA[_i] * 2); } while (0)
    Unit cur, nxt; int ui = 0;
    if (!S.next(0, cur)) return;
    f32x4 acc[2][2][4][2];
#pragma unroll
    for (int a = 0; a < 2; ++a)
#pragma unroll
        for (int b = 0; b < 2; ++b)
#pragma unroll
            for (int m = 0; m < 4; ++m)
#pragma unroll
                for (int n = 0; n < 2; ++n) acc[a][b][m][n] = (f32x4){0.f, 0.f, 0.f, 0.f};
    bf16x8 At[4][2], B0[2][2], B1[2][2];
    unsigned offC[2][2];
    PG8_ROWS(offC, 0);
    const char* gA = (const char*)g.A;
    const char* cB = (const char*)g.Bt + (size_t)cur.pn * tstepB;
    PG8_STAGE(PG8_SB(0, 0), cB, voffB); PG8_STAGE(PG8_SB(0, 1), cB + hstepB, voffB); PG8_STAGE(PG8_SA(0, 0), gA, offC[0]); PG8_STAGE(PG8_SA(0, 1), gA, offC[1]);
    if (wr == 1) PG8_BAR;
    PG8_WAIT_V(2); PG8_BAR;
    PG8_STAGE(PG8_SB(1, 0), cB + kstep, voffB); PG8_STAGE(PG8_SA(1, 0), gA + kstep, offC[0]); PG8_STAGE(PG8_SB(1, 1), cB + hstepB + kstep, voffB);
    PG8_WAIT_V(6); PG8_BAR;
    for (;;) {
        const bool has_next = S.next(ui + 1, nxt);
        const char* nB = has_next ? (const char*)g.Bt + (size_t)nxt.pn * tstepB : cB;
        for (int t = 0; t < nt; t += 2) {
            const bool last = (t == nt - 2);
            const char* a1 = gA + (size_t)(t + 1) * kstep;
            const char* a2 = last ? gA : gA + (size_t)(t + 2) * kstep; const char* b2 = last ? nB : cB + (size_t)(t + 2) * kstep;
            const char* a3 = a2 + kstep; const char* b3 = b2 + kstep;
            PG8_LDB(B0, 0, 0); PG8_LDB(B1, 0, 1); PG8_SCHED; PG8_LDA(At, 0, 0); PG8_STAGE(PG8_SA(1, 1), a1, offC[1]);
            if (last && has_next) { PG8_ROWS(offC, ui + 1); }
            PG8_WAIT_V(8); PG8_WAIT_L(0); PG8_BAR; PG8_MMA(0, 0, At, B0); PG8_MMA(0, 1, At, B1); PG8_BAR; PG8_SCHED;
            PG8_LDA(At, 0, 1); PG8_STAGE(PG8_SB(0, 0), b2, voffB); PG8_STAGE(PG8_SB(0, 1), b2 + hstepB, voffB); PG8_STAGE(PG8_SA(0, 0), a2, offC[0]);
            PG8_WAIT_V(8); PG8_WAIT_L(0); PG8_BAR; PG8_MMA(1, 0, At, B0); PG8_MMA(1, 1, At, B1); PG8_BAR; PG8_SCHED;
            PG8_LDB(B0, 1, 0); PG8_LDB(B1, 1, 1); PG8_SCHED; PG8_LDA(At, 1, 0); PG8_STAGE(PG8_SA(0, 1), a2, offC[1]);
            PG8_WAIT_V(8); PG8_WAIT_L(0); PG8_BAR; PG8_MMA(0, 0, At, B0); PG8_MMA(0, 1, At, B1); PG8_BAR; PG8_SCHED;
            PG8_LDA(At, 1, 1); PG8_STAGE(PG8_SB(1, 0), b3, voffB); PG8_STAGE(PG8_SB(1, 1), b3 + hstepB, voffB); PG8_STAGE(PG8_SA(1, 0), a3, offC[0]);
            PG8_WAIT_V(8); PG8_WAIT_L(0); PG8_BAR; PG8_MMA(1, 0, At, B0); PG8_MMA(1, 1, At, B1); PG8_BAR; PG8_SCHED;
        }
        if (wr == 0) PG8_BAR;
        E(acc, cur, wr, wc, fr, fq); S.done(cur);
        if (!has_next) break;
#pragma unroll
        for (int a = 0; a < 2; ++a)
#pragma unroll
            for (int b = 0; b < 2; ++b)
#pragma unroll
                for (int m = 0; m < 4; ++m)
#pragma unroll
                    for (int n = 0; n < 2; ++n) acc[a][b][m][n] = (f32x4){0.f, 0.f, 0.f, 0.f};
        cur = nxt; cB = nB; ++ui;
        if (wr == 1) PG8_BAR;
    }
    PG8_WAIT_V(0);
    PG8_BAR;
#undef PG8_ROWS
#undef PG8_SA
#undef PG8_SB
#undef PG8_STAGE
#undef PG8_LDA
#undef PG8_LDB
#undef PG8_MMA
#undef PG8_WAIT_V
#undef PG8_WAIT_L
#undef PG8_BAR
#undef PG8_SCHED
}
}

constexpr int T = 8192, D = 2048, NL = 2, BW = 512, ZC = 14336, INC = 14352;
constexpr int NE = 64, NEX = 65  , ED = 512;
constexpr int HK = NEX * ED;
constexpr float ALPHA = 1.41421356237f;
constexpr float LN_EPS = 1e-5f;
constexpr int ZC_SBQ = 0, ZC_SBK = 512, ZC_SBV = 1024, ZC_GMU = 1536, ZC_GMV = 2048, ZC_GDN = 2560, ZC_GDNG = 4096,
              ZC_MLQ = 4608, ZC_MLK = 4864, ZC_MLV = 5120, ZC_MLO = 5632, ZC_GATE = 6144;

#define GAS __attribute__((address_space(1)))
#define LAS __attribute__((address_space(3)))
typedef unsigned short bf16;
typedef unsigned v4u __attribute__((ext_vector_type(4)));
typedef unsigned v2u __attribute__((ext_vector_type(2)));
typedef float v4f __attribute__((ext_vector_type(4)));
typedef float v2f __attribute__((ext_vector_type(2)));
#define LDS_WAIT() asm volatile("s_waitcnt lgkmcnt(0)" ::: "memory")

constexpr size_t MiB = 1u << 20;
constexpr size_t WS_CTL = 0, CTL_ZERO_BYTES = 1 * MiB;
constexpr size_t WS_WIN = 2 * MiB, WS_WBR = 58 * MiB, WS_WOUT = 66 * MiB, WS_WUP = 74 * MiB, WS_WDN = 334 * MiB;
constexpr size_t WS_XB = 464 * MiB, WS_SMALL = 496 * MiB, WS_EG = 497 * MiB, WS_BETA = WS_EG + 256 * 1024, WS_COMB = 498 * MiB;
constexpr size_t WS_Z = 500 * MiB, WS_GQ = 724 * MiB, WS_GK = 740 * MiB, WS_GV = 756 * MiB, WS_GO = 772 * MiB, WS_HO = 788 * MiB;
constexpr size_t WS_BR = 804 * MiB, WS_MTMP = 836 * MiB, WS_MSUM = 900 * MiB, WS_Y = 932 * MiB, WS_X1 = 996 * MiB, WS_X1B = 1060 * MiB;
constexpr size_t WS_XCUR = 1092 * MiB, WS_HB = 1156 * MiB, WS_YEXP = 1236 * MiB, WS_LIST = 1524 * MiB, WS_WL = 1526 * MiB, WS_SLOT = 1528 * MiB, WS_MQ = 1530 * MiB, WS_MS = 1534 * MiB, WS_MK = 1538 * MiB, WS_MV = 1542 * MiB, WS_MFL = 1552 * MiB, WS_HDEN = WS_MFL + 65536, WS_END = 1553 * MiB;
constexpr size_t WS_GU = WS_GQ, WS_GNW = WS_GK, WS_GQG = WS_GK + 8 * MiB, WS_GKT = WS_GV, WS_GAT = WS_GV + 8 * MiB, WS_GDL = WS_GV + 12 * MiB;
constexpr int HROWS = 73728;
static_assert(WS_HB + (size_t)HROWS * ED * 2 <= WS_YEXP && WS_YEXP + (size_t)HROWS * D * 2 <= WS_LIST, "ws map (moe)");
static_assert(WS_WIN + (size_t)ZC * D * 2 <= WS_WBR && WS_WUP + (size_t)NEX * 1024 * D * 2 <= WS_WDN && WS_WDN + (size_t)D * HK * 2 <= WS_XB, "ws map (weights)");
static_assert(WS_Z + (size_t)T * ZC * 2 <= WS_GQ, "ws map (acts)");
constexpr int CW_BAR = 4096, CW_CNT = 16384;
constexpr int TAB_OFF = 131072 + 1024;
constexpr int LDS_BYTES = 147456, MISC_OFF = 131072 + 320;

__device__ __forceinline__ float bflo(unsigned w) { return __uint_as_float(w << 16); }
__device__ __forceinline__ float bfhi(unsigned w) { return __uint_as_float(w & 0xffff0000u); }
__device__ __forceinline__ unsigned f2bf(float f) { unsigned u = __float_as_uint(f); return (u + 0x7fffu + ((u >> 16) & 1u)) >> 16; }
__device__ __forceinline__ unsigned pk2(float lo, float hi) { return f2bf(lo) | (f2bf(hi) << 16); }
template <int CTRL> __device__ __forceinline__ float dpp(float x) { return __builtin_bit_cast(float, __builtin_amdgcn_mov_dpp(__builtin_bit_cast(int, x), CTRL, 0xf, 0xf, true)); }
__device__ __forceinline__ float sum4(float x) { x += dpp<0xB1>(x); x += dpp<0x4E>(x); return x; }
__device__ __forceinline__ float sum8(float x) { x = sum4(x); x += dpp<0x141>(x); return x; }
__device__ __forceinline__ float sum16(float x) { x = sum8(x); x += dpp<0x140>(x); return x; }
__device__ __forceinline__ float wave_sum(float x) { x = sum16(x); x += __shfl_xor(x, 16); x += __shfl_xor(x, 32); return x; }
__device__ __forceinline__ float max8(float x) { x = fmaxf(x, dpp<0xB1>(x)); x = fmaxf(x, dpp<0x4E>(x)); x = fmaxf(x, dpp<0x141>(x)); return x; }
__device__ __forceinline__ float min8(float x) { x = fminf(x, dpp<0xB1>(x)); x = fminf(x, dpp<0x4E>(x)); x = fminf(x, dpp<0x141>(x)); return x; }
__device__ __forceinline__ float wave_scan_incl(float v) {
    v += __builtin_bit_cast(float, __builtin_amdgcn_update_dpp(0, __builtin_bit_cast(int, v), 0x111, 0xf, 0xf, true));
    v += __builtin_bit_cast(float, __builtin_amdgcn_update_dpp(0, __builtin_bit_cast(int, v), 0x112, 0xf, 0xf, true));
    v += __builtin_bit_cast(float, __builtin_amdgcn_update_dpp(0, __builtin_bit_cast(int, v), 0x114, 0xf, 0xf, true));
    v += __builtin_bit_cast(float, __builtin_amdgcn_update_dpp(0, __builtin_bit_cast(int, v), 0x118, 0xf, 0xf, true));
    v += __builtin_bit_cast(float, __builtin_amdgcn_update_dpp(0, __builtin_bit_cast(int, v), 0x142, 0xa, 0xf, false));
    v += __builtin_bit_cast(float, __builtin_amdgcn_update_dpp(0, __builtin_bit_cast(int, v), 0x143, 0xc, 0xf, false));
    return v;
}
__device__ __forceinline__ float sigmoidf_(float x) { return 1.f / (1.f + __expf(-x)); }
__device__ __forceinline__ float siluf_(float x) { return x / (1.f + __expf(-x)); }
__device__ __forceinline__ float softplusf_(float x) { return fmaxf(x, 0.f) + __logf(1.f + __expf(-fabsf(x))); }
__device__ __forceinline__ float gelu_tanh(float x) { const float y = 0.7978845608f * (x + 0.044715f * x * x * x); const float t = 1.f - 2.f / (__expf(2.f * y) + 1.f); return 0.5f * x * (1.f + t); }
__device__ __forceinline__ void unpack8(const v4u r, float (&f)[8]) { f[0] = bflo(r.x); f[1] = bfhi(r.x); f[2] = bflo(r.y); f[3] = bfhi(r.y); f[4] = bflo(r.z); f[5] = bfhi(r.z); f[6] = bflo(r.w); f[7] = bfhi(r.w); }
#define XB_TMO      128
#define XB_XCNT(j)  (256  + 64 * (j))
#define XB_XSUB(j)  (1280 + 64 * (j))
#define XB_XGEN(j)  (2304 + 64 * (j))
#define XB_TOP      3328
#define XB_TOPGEN   3392
#define XCD_BAR_WORDS 3456
#define XB_SPIN_CAP (1u << 18)

__device__ __forceinline__ unsigned xb_ld(unsigned* p)              { return __hip_atomic_load(p, __ATOMIC_RELAXED, __HIP_MEMORY_SCOPE_AGENT); }
__device__ __forceinline__ unsigned xb_add(unsigned* p, unsigned v) { return __hip_atomic_fetch_add(p, v, __ATOMIC_RELAXED, __HIP_MEMORY_SCOPE_AGENT); }
__device__ __forceinline__ unsigned xb_xcc_id() { return (unsigned)__builtin_amdgcn_s_getreg((3 << 11) | 20) & 0xFu; }
#define XB_SPIN(cond, bar) do { unsigned _sp = 0; while (cond) { __builtin_amdgcn_s_sleep(1); \
    if ((++_sp & 255u) == 0u) { if (xb_ld(&(bar)[XB_TMO])) break; if (_sp > XB_SPIN_CAP) { atomicAdd(&(bar)[XB_TMO], 1u); break; } } } } while (0)

struct XcdBarrier {
    unsigned* bar; unsigned x;
    volatile LAS unsigned* st;
};

__device__ __forceinline__ XcdBarrier xcd_barrier_post(unsigned* bar, volatile LAS unsigned* st) {
    XcdBarrier b; b.bar = bar; b.x = xb_xcc_id(); b.st = st;
    if (threadIdx.x == 0) (void)xb_add(&bar[XB_XCNT(b.x)], 1u);
    return b;
}
__device__ __forceinline__ void xcd_barrier_complete(unsigned* bar, unsigned x, unsigned& nloc, unsigned& nx) {
    const unsigned G = gridDim.x * gridDim.y * gridDim.z;
    unsigned sum, cnt, mine, sp = 0u;
    for (;;) {
        sum = 0u; cnt = 0u; mine = 0u;
#pragma unroll
        for (unsigned j = 0; j < 16; ++j) { const unsigned c = xb_ld(&bar[XB_XCNT(j)]); sum += c; cnt += (c > 0u) ? 1u : 0u; mine = (j == x) ? c : mine; }
        if (sum == G) break;
        __builtin_amdgcn_s_sleep(1);
        if ((++sp & 255u) == 0u) { if (xb_ld(&bar[XB_TMO])) break; if (sp > XB_SPIN_CAP) { atomicAdd(&bar[XB_TMO], 1u); break; } }
    }
    nloc = mine > 0u ? mine : 1u; nx = cnt > 0u ? cnt : 1u;
}

__device__ __forceinline__ void xcd_barrier(const XcdBarrier& b) {
    asm volatile("s_waitcnt vmcnt(0)" ::: "memory");
    __syncthreads();
    if (threadIdx.x == 0) {
        unsigned* bar = b.bar;
        __builtin_amdgcn_s_waitcnt(0);
        unsigned nloc = b.st[0], nx = b.st[1];
        if (nloc == 0u) { xcd_barrier_complete(bar, b.x, nloc, nx); b.st[0] = nloc; b.st[1] = nx; }
        const unsigned old = xb_add(&bar[XB_XSUB(b.x)], 1u);
        const unsigned gen = old / nloc;
        if (old + 1u == (gen + 1u) * nloc) {
            __builtin_amdgcn_fence(__ATOMIC_RELEASE, "agent");
            asm volatile("s_waitcnt vmcnt(0)" ::: "memory");
            const unsigned og = xb_add(&bar[XB_TOP], 1u);
            const unsigned tg = og / nx;
            if (og + 1u == (tg + 1u) * nx) xb_add(&bar[XB_TOPGEN], 1u);
            else XB_SPIN(xb_ld(&bar[XB_TOPGEN]) == tg, bar);
            __builtin_amdgcn_fence(__ATOMIC_ACQUIRE, "agent");
            xb_add(&bar[XB_XGEN(b.x)], 1u);
            asm volatile("s_waitcnt vmcnt(0)" ::: "memory");
        } else {
            XB_SPIN(xb_ld(&bar[XB_XGEN(b.x)]) == gen, bar);
            __builtin_amdgcn_fence(__ATOMIC_ACQUIRE, "agent");
            asm volatile("s_waitcnt vmcnt(0)" ::: "memory");
        }
    }
    __syncthreads();
}

struct Params { const float* in[27]; float* out; unsigned char* ws; int ph_lo, ph_hi; };
enum { I_X = 0, I_WIN, I_GMNG, I_GMNB, I_GMWS, I_GMBS, I_CONVW, I_ALOG, I_DTB, I_GDNNG, I_MLIB, I_MLFB, I_MLNG, I_WBR, I_WOUT, I_LN1G, I_LN1B,
       I_WR, I_RB, I_WG, I_WU, I_WD, I_SG, I_SU, I_SD, I_LN2G, I_LN2B };

using pg8::f32x4; using pg8::u32x4; using pg8::Unit; using pg8::HALF; using pg8::BM;

struct MergeOrder {
    int G, c;
    __device__ bool next(int i, Unit& u) const {
        const long L = (long)(i >> 2) * G + c; if (L >= 256) return false;
        const int g = i & 3; int wgid = (int)L; { const int q = 256 / 8, xcd = wgid % 8, off = wgid / 8; wgid = xcd * q + off; }
        const int nN = 8, nig = 8 * nN, gid = wgid / nig, fm = gid * 8; const int pm = fm + ((wgid % nig) % 8), pn = (wgid % nig) / 8;
        u.pm = g * 32 + pm; u.pn = g * 8 + pn; return true;
    }
    __device__ __forceinline__ void a_ready(const Unit&) const {}
    __device__ __forceinline__ void done(const Unit&) const {}
};
struct EpiMerge {
    static constexpr bool PERM = true, AFTER_DRAIN = false;
    const bf16* Z; float* tmp; bf16* msum;
    __device__ __forceinline__ void operator()(const f32x4 (&acc)[2][2][4][2], const Unit& u, int wr, int wc, int fr, int fq) const {
        const int g = u.pm >> 5, pm = u.pm & 31, pn = u.pn & 7;
        const int row0 = pm * BM + wr * 64 + fr, col0 = pn * BM + wc * 32 + 8 * fq;
#pragma unroll
        for (int ai = 0; ai < 2; ++ai)
#pragma unroll
            for (int m = 0; m < 4; ++m) { const size_t row = (size_t)(row0 + ai * HALF + m * 16);
#pragma unroll
                for (int bj = 0; bj < 2; ++bj) { const int col = col0 + bj * HALF;
                    const v4u gr = *(const v4u*)(Z + row * ZC + ZC_GATE + g * D + col); float gl[8]; unpack8(gr, gl);
                    float* tp = tmp + row * D + col; f32x4 v0 = acc[ai][bj][m][0], v1 = acc[ai][bj][m][1];
#pragma unroll
                    for (int j = 0; j < 4; ++j) { v0[j] *= sigmoidf_(gl[j]); v1[j] *= sigmoidf_(gl[4 + j]); }
                    if (g > 0) { v0 += *(const f32x4*)tp; v1 += *(const f32x4*)(tp + 4); }
                    if (g < 3) { *(f32x4*)tp = v0; *(f32x4*)(tp + 4) = v1; }
                    else { u32x4 w; w.x = pk2(v0[0], v0[1]); w.y = pk2(v0[2], v0[3]); w.z = pk2(v1[0], v1[1]); w.w = pk2(v1[2], v1[3]); *(u32x4*)(msum + row * D + col) = w; } }
                asm volatile("" ::: "memory"); }
    }
};
struct EpiResid {
    static constexpr bool PERM = false, AFTER_DRAIN = false;
    const float* X; float* Y;
    __device__ __forceinline__ void operator()(const f32x4 (&acc)[2][2][4][2], const Unit& u, int wr, int wc, int fr, int fq) const {
        const int row0 = u.pm * BM + wr * 64 + fr, col0 = u.pn * BM + wc * 32 + 4 * fq;
#pragma unroll
        for (int ai = 0; ai < 2; ++ai)
#pragma unroll
            for (int m = 0; m < 4; ++m) { const size_t off = (size_t)(row0 + ai * HALF + m * 16) * D + col0;
#pragma unroll
                for (int bj = 0; bj < 2; ++bj)
#pragma unroll
                    for (int n = 0; n < 2; ++n) { const f32x4 xv = *(const f32x4*)(X + off + bj * HALF + n * 16); *(f32x4*)(Y + off + bj * HALF + n * 16) = xv * ALPHA + acc[ai][bj][m][n]; } }
    }
};
struct MoeTab {
    LAS int* t; LAS unsigned short* tok; LAS float* wt; LAS unsigned char* mte;
    __device__ __forceinline__ MoeTab(LAS unsigned char* lds) : t((LAS int*)(lds + TAB_OFF)), tok((LAS unsigned short*)(lds + TAB_OFF + 1024)), wt((LAS float*)(lds + TAB_OFF + 5120)), mte((LAS unsigned char*)(lds + TAB_OFF + 13312)) {}
};
__device__ __forceinline__ void moe_tables(const MoeTab& M, const unsigned* cnt  , int tid, int lane, int wave) {
    __syncthreads();
    if (wave == 0) { const int c = (int)cnt[64 * lane]; const int tiles = (c + 255) >> 8; const float incl = wave_scan_incl((float)tiles);
        M.t[80 + lane] = c; M.t[lane] = (int)incl - tiles; if (lane == 63) { M.t[64] = (int)incl; M.t[65] = (int)incl + T / 256; M.t[80 + 64] = T; } }
    __syncthreads();
    const int Mt = M.t[65];
    for (int mt = tid; mt < Mt; mt += 512) { int e = 0;
        for (int k = 1; k <= 64; ++k) e = (M.t[k] <= mt) ? k : e;
        M.mte[mt] = (unsigned char)e; }
    __syncthreads();
}
struct UpOrder {
    MoeTab M; int n;
    __device__ __forceinline__ bool next(int i, Unit& u) const { if (i >= n) return false; u.pm = M.t[168 + i]; u.pn = M.t[176 + i]; u.aux = i; return true; }
    __device__ __forceinline__ int row_token(int i, int r) const { return (int)M.tok[i * 256 + r]; }
    __device__ __forceinline__ void a_ready(const Unit&) const {}
    __device__ __forceinline__ void done(const Unit&) const {}
};
__device__ __forceinline__ int up_order_build(const MoeTab& M, const int* LIST, const float* WL, int wg, int G, int tid) {
    const int U = 4 * M.t[65];
    if (tid < 8) { const int L = tid * G + wg; if (L < U) { const int mt = L >> 2, q = L & 3, e = M.mte[mt]; M.t[168 + tid] = mt; M.t[176 + tid] = e * 4 + q; M.t[184 + tid] = e; M.t[192 + tid] = mt - M.t[e]; } }
    int n = 0;
#pragma unroll
    for (int i = 0; i < 8; ++i) n += (i * G + wg < U) ? 1 : 0;
    __syncthreads();
    for (int idx = tid; idx < n * 256; idx += 512) { const int i = idx >> 8, r = idx & 255, e = M.t[184 + i], li = M.t[192 + i] * 256 + r;
        int tk = 0; float w = 0.f;
        if (e < NE) { if (li < M.t[80 + e]) { tk = LIST[e * T + li]; w = WL[e * T + li]; } } else { tk = li; w = 1.f; }
        M.tok[idx] = (unsigned short)tk; M.wt[idx] = w; }
    __syncthreads();
    return n;
}
struct EpiGluSparse {
    static constexpr bool PERM = true, AFTER_DRAIN = false;
    LAS const float* wt; bf16* H;
    __device__ __forceinline__ void operator()(const f32x4 (&acc)[2][2][4][2], const Unit& u, int wr, int wc, int fr, int fq) const {
        const int q = u.pn & 3; const int rl0 = wr * 64 + fr, col0 = q * 128 + wc * 32 + 8 * fq;
#pragma unroll
        for (int ai = 0; ai < 2; ++ai)
#pragma unroll
            for (int m = 0; m < 4; ++m) { const int rl = rl0 + ai * HALF + m * 16; const float c = wt[u.aux * 256 + rl]; float h[8];
#pragma unroll
                for (int n = 0; n < 2; ++n)
#pragma unroll
                    for (int j = 0; j < 4; ++j) h[4 * n + j] = siluf_(acc[ai][0][m][n][j]) * acc[ai][1][m][n][j] * c;
                u32x4 w; w.x = pk2(h[0], h[1]); w.y = pk2(h[2], h[3]); w.z = pk2(h[4], h[5]); w.w = pk2(h[6], h[7]);
                *(u32x4*)(H + ((size_t)u.pm * 256 + rl) * ED + col0) = w; }
    }
};
struct DownOrder {
    MoeTab M; int G, c, U;
    __device__ __forceinline__ bool next(int i, Unit& u) const { const int L = i * G + c; if (L >= U) return false; const int mt = L >> 3; u.pm = mt; u.pn = (int)M.mte[mt] * 8 + (L & 7); u.aux = 0; return true; }
    __device__ __forceinline__ void a_ready(const Unit&) const {}
    __device__ __forceinline__ void done(const Unit&) const {}
};
struct EpiYexp {
    static constexpr bool PERM = true, AFTER_DRAIN = false;
    bf16* Y;
    __device__ __forceinline__ void operator()(const f32x4 (&acc)[2][2][4][2], const Unit& u, int wr, int wc, int fr, int fq) const {
        const int row0 = u.pm * BM + wr * 64 + fr, col0 = (u.pn & 7) * BM + wc * 32 + 8 * fq;
#pragma unroll
        for (int ai = 0; ai < 2; ++ai)
#pragma unroll
            for (int m = 0; m < 4; ++m) { bf16* rowp = Y + (size_t)(row0 + ai * HALF + m * 16) * D + col0;
#pragma unroll
                for (int bj = 0; bj < 2; ++bj) { const f32x4 v0 = acc[ai][bj][m][0], v1 = acc[ai][bj][m][1];
                    u32x4 w; w.x = pk2(v0[0], v0[1]); w.y = pk2(v0[2], v0[3]); w.z = pk2(v1[0], v1[1]); w.w = pk2(v1[2], v1[3]); *(u32x4*)(rowp + bj * HALF) = w; } }
    }
};

__device__ __forceinline__ void tr_item(const float* src, size_t sld, bf16* dst, size_t dld, LAS float* scr, int lane) {
#pragma unroll 8
    for (int i = 0; i < 32; ++i) { const int kk = 2 * i + (lane >> 5); scr[kk * 33 + (lane & 31)] = src[(size_t)kk * sld + (lane & 31)]; }
    LDS_WAIT(); asm volatile("" ::: "memory");
    const int c = lane & 7;
#pragma unroll
    for (int j = 0; j < 4; ++j) { const int n = (lane >> 3) + 8 * j; const LAS float* s = scr + (8 * c) * 33 + n;
        v4u o; o.x = pk2(s[0 * 33], s[1 * 33]); o.y = pk2(s[2 * 33], s[3 * 33]); o.z = pk2(s[4 * 33], s[5 * 33]); o.w = pk2(s[6 * 33], s[7 * 33]);
        *(v4u*)(dst + (size_t)n * dld + 8 * c) = o; }
    LDS_WAIT(); asm volatile("" ::: "memory");
}
__device__ __forceinline__ void phase_convert(const Params& p, int l, LAS unsigned char* lds, int gw, int NGW, int wave, int lane) {
    unsigned char* ws = p.ws;
    const float* w_in = p.in[I_WIN] + (size_t)l * D * INC; const float* w_br = p.in[I_WBR] + (size_t)l * 4 * BW * D; const float* w_out = p.in[I_WOUT] + (size_t)l * D * D;
    const float* w_g = p.in[I_WG] + (size_t)l * NE * D * ED; const float* w_u = p.in[I_WU] + (size_t)l * NE * D * ED; const float* w_d = p.in[I_WD] + (size_t)l * NE * ED * D;
    const float* s_g = p.in[I_SG] + (size_t)l * D * ED; const float* s_u = p.in[I_SU] + (size_t)l * D * ED; const float* s_d = p.in[I_SD] + (size_t)l * ED * D;
    bf16* WIN = (bf16*)(ws + WS_WIN); bf16* WBR = (bf16*)(ws + WS_WBR); bf16* WOUT = (bf16*)(ws + WS_WOUT); bf16* WUP = (bf16*)(ws + WS_WUP); bf16* WDN = (bf16*)(ws + WS_WDN);
    LAS float* scr = (LAS float*)(lds + wave * 16384);
    constexpr int N_IN = (ZC / 32) * (D / 64), N_BR = 4 * (BW / 64) * (D / 32), N_OUT = (D / 64) * (D / 32), N_UP = NEX * 2 * (D / 64) * (ED / 32), N_DN = NEX * (ED / 64) * (D / 32);
    constexpr int NITEMS = N_IN + N_BR + N_OUT + N_UP + N_DN;
    for (int it = gw; it < NITEMS; it += NGW) {
        int r = it;
        if (r < N_IN) { const int kb = r / (ZC / 32), n0 = (r % (ZC / 32)) * 32, k0 = kb * 64; const int sc = n0 + (n0 >= ZC_GATE ? 16 : (n0 >= ZC_MLQ ? 8 : 0));
            tr_item(w_in + (size_t)k0 * INC + sc, INC, WIN + (size_t)n0 * D + k0, D, scr, lane); continue; } r -= N_IN;
        if (r < N_BR) { const int g = r / 512, rr = r % 512, k0 = (rr / 64) * 64, n0 = (rr % 64) * 32;
            tr_item(w_br + ((size_t)g * BW + k0) * D + n0, D, WBR + ((size_t)g * D + n0) * BW + k0, BW, scr, lane); continue; } r -= N_BR;
        if (r < N_OUT) { const int k0 = (r / 64) * 64, n0 = (r % 64) * 32;
            tr_item(w_out + (size_t)k0 * D + n0, D, WOUT + (size_t)n0 * D + k0, D, scr, lane); continue; } r -= N_OUT;
        if (r < N_UP) { const int e = r / 1024, rr = r % 1024, mat = rr / 512, r2 = rr % 512, k0 = (r2 / 16) * 64, n0 = (r2 % 16) * 32;
            const float* sb = (e < NE) ? ((mat ? w_u : w_g) + (size_t)e * D * ED) : (mat ? s_u : s_g);
            const int drow = e * 1024 + (n0 / 128) * 256 + mat * 128 + (n0 % 128);
            tr_item(sb + (size_t)k0 * ED + n0, ED, WUP + (size_t)drow * D + k0, D, scr, lane); continue; } r -= N_UP;
        { const int e = r / 512, rr = r % 512, k0 = (rr / 64) * 64, n0 = (rr % 64) * 32;
            const float* sb = (e < NE) ? (w_d + (size_t)e * ED * D) : s_d;
            tr_item(sb + (size_t)k0 * D + n0, D, WDN + ((size_t)e * D + n0) * ED + k0, ED, scr, lane); }
    }
}
__device__ __forceinline__ void phase_xprep(const Params& p, int l, const float* xin, LAS unsigned char* lds, int gw, int NGW, int tid, int lane) {
    const float* w_in = p.in[I_WIN] + (size_t)l * D * INC; LAS float* wsm = (LAS float*)lds;
    __syncthreads();
    for (int idx = tid; idx < D * 16; idx += 512) { const int d = idx >> 4, c = idx & 15; wsm[c * D + d] = w_in[(size_t)d * INC + (c < 8 ? 4608 + c : 6152 + (c - 8))]; }
    __syncthreads();
    bf16* XB = (bf16*)(p.ws + WS_XB); float* SMALL = (float*)(p.ws + WS_SMALL);
    for (int m = gw; m < T; m += NGW) {
        const v4f* xr = (const v4f*)(xin + (size_t)m * D) + lane; v4f v[8];
#pragma unroll
        for (int j = 0; j < 8; ++j) v[j] = xr[64 * j];
        v2u* xo = (v2u*)(XB + (size_t)m * D) + lane;
#pragma unroll
        for (int j = 0; j < 8; ++j) { v2u o; o.x = pk2(v[j].x, v[j].y); o.y = pk2(v[j].z, v[j].w); xo[64 * j] = o; }
        float res = 0.f;
#pragma unroll 1
        for (int c = 0; c < 16; ++c) { float a = 0.f;
#pragma unroll
            for (int j = 0; j < 8; ++j) { const v4f w = *(const LAS v4f*)(wsm + c * D + 4 * lane + 256 * j); a += v[j].x * w.x + v[j].y * w.y + v[j].z * w.z + v[j].w * w.w; }
            a = wave_sum(a); if (lane == c) res = a; }
        if (lane < 16) SMALL[(size_t)m * 16 + lane] = res;
    }
    __syncthreads();
}


typedef short bf16x8_t __attribute__((ext_vector_type(8)));
__device__ __forceinline__ void ml_pre_item(const Params& p, int l, LAS unsigned char* lds, int item, int tid, int wave, int lane) {
    const int h = item & 3, n = item >> 2; const size_t t0 = (size_t)n * 64;
    const bf16* Z = (const bf16*)(p.ws + WS_Z); const float* SMALL = (const float*)(p.ws + WS_SMALL);
    bf16* MQ = (bf16*)(p.ws + WS_MQ) + (size_t)item * 4096; bf16* MS = (bf16*)(p.ws + WS_MS) + (size_t)item * 4096; bf16* MK = (bf16*)(p.ws + WS_MK) + (size_t)item * 4096;
    bf16* MV = (bf16*)(p.ws + WS_MV) + (size_t)item * 9216; float* MFL = (float*)(p.ws + WS_MFL);
    LAS float* qs = (LAS float*)lds;
    LAS float* ks = qs + 64 * 65;
    LAS float* bs = ks + 64 * 65;
    LAS unsigned short* vs = (LAS unsigned short*)(bs + 128);
    { const int tk = tid >> 3, c8 = tid & 7; float f[8];
      unpack8(*(const v4u*)(Z + (t0 + tk) * ZC + ZC_MLQ + h * 64 + 8 * c8), f);
#pragma unroll
      for (int i = 0; i < 8; ++i) qs[tk * 65 + 8 * c8 + i] = f[i];
      unpack8(*(const v4u*)(Z + (t0 + tk) * ZC + ZC_MLK + h * 64 + 8 * c8), f);
#pragma unroll
      for (int i = 0; i < 8; ++i) ks[tk * 65 + 8 * c8 + i] = f[i]; }
#pragma unroll
    for (int r = 0; r < 2; ++r) { const int idx = tid + 512 * r, tk = idx >> 4, c8 = idx & 15;
        *(LAS v4u*)(vs + tk * 136 + 8 * c8) = *(const v4u*)(Z + (t0 + tk) * ZC + ZC_MLV + h * 128 + 8 * c8); }
    if (wave == 0) { const float fp = SMALL[(t0 + lane) * 16 + 12 + h] + p.in[I_MLFB][l * 4 + h]; const float lf = -softplusf_(-fp);
        bs[lane] = wave_scan_incl(lf); bs[64 + lane] = SMALL[(t0 + lane) * 16 + 8 + h] + p.in[I_MLIB][l * 4 + h]; }
    __syncthreads();
    const float blast = bs[63];
    { const int i = tid >> 3, jb = tid & 7; const float bi = bs[i];
      { const float e = __expf(bi) * 0.125f; float o[8];
#pragma unroll
        for (int x = 0; x < 8; ++x) o[x] = qs[i * 65 + 8 * jb + x] * e;
        v4u w; w.x = pk2(o[0], o[1]); w.y = pk2(o[2], o[3]); w.z = pk2(o[4], o[5]); w.w = pk2(o[6], o[7]); *(v4u*)(MQ + i * 64 + 8 * jb) = w; }
      { float d[8];
#pragma unroll
        for (int x = 0; x < 8; ++x) d[x] = 0.f;
        if (8 * jb <= i) {
            for (int dd = 0; dd < 64; ++dd) { const float qv = qs[i * 65 + dd];
#pragma unroll
                for (int x = 0; x < 8; ++x) d[x] += qv * ks[(8 * jb + x) * 65 + dd]; }
#pragma unroll
            for (int x = 0; x < 8; ++x) { const int j = 8 * jb + x; d[x] = (j <= i) ? __expf(bi - bs[j] + bs[64 + j]) * d[x] * 0.125f : 0.f; } }
        v4u w; w.x = pk2(d[0], d[1]); w.y = pk2(d[2], d[3]); w.z = pk2(d[4], d[5]); w.w = pk2(d[6], d[7]); *(v4u*)(MS + i * 64 + 8 * jb) = w; }
      { float o[8];
#pragma unroll
        for (int x = 0; x < 8; ++x) { const int j = 8 * jb + x; o[x] = ks[j * 65 + i] * __expf(blast - bs[j] + bs[64 + j]); }
        v4u w; w.x = pk2(o[0], o[1]); w.y = pk2(o[2], o[3]); w.z = pk2(o[4], o[5]); w.w = pk2(o[6], o[7]); *(v4u*)(MK + i * 64 + 8 * jb) = w; }
    }
    { const int c = tid >> 2, jq = tid & 3; unsigned w[8];
#pragma unroll
      for (int x = 0; x < 8; ++x) w[x] = (unsigned)vs[(16 * jq + 2 * x) * 136 + c] | ((unsigned)vs[(16 * jq + 2 * x + 1) * 136 + c] << 16);
      *(v4u*)(MV + c * 64 + 16 * jq) = (v4u){w[0], w[1], w[2], w[3]}; *(v4u*)(MV + c * 64 + 16 * jq + 8) = (v4u){w[4], w[5], w[6], w[7]};
      if (tid < 64) { const int c2 = 128 + (tid >> 2); const unsigned one = (c2 == 128) ? 0x3F803F80u : 0u;
          *(v4u*)(MV + c2 * 64 + 16 * jq) = (v4u){one, one, one, one}; *(v4u*)(MV + c2 * 64 + 16 * jq + 8) = (v4u){one, one, one, one}; } }
    if (tid == 0) MFL[item] = __expf(blast);
    __syncthreads();
}
struct MlFrags { bf16x8_t q[2], s[2], kt[2], vt[2]; float fl; };
__device__ __forceinline__ void ml_load(MlFrags& F, const Params& p, int item, int offA, int offV) {
    const bf16* MQ = (const bf16*)(p.ws + WS_MQ) + (size_t)item * 4096; const bf16* MS = (const bf16*)(p.ws + WS_MS) + (size_t)item * 4096; const bf16* MK = (const bf16*)(p.ws + WS_MK) + (size_t)item * 4096;
    const bf16* MV = (const bf16*)(p.ws + WS_MV) + (size_t)item * 9216;
#pragma unroll
    for (int ks = 0; ks < 2; ++ks) { F.q[ks] = *(const bf16x8_t*)(MQ + offA + 32 * ks); F.s[ks] = *(const bf16x8_t*)(MS + offA + 32 * ks); F.kt[ks] = *(const bf16x8_t*)(MK + offA + 32 * ks); F.vt[ks] = *(const bf16x8_t*)(MV + offV + 32 * ks); }
    F.fl = ((const float*)(p.ws + WS_MFL))[item];
}
__device__ __forceinline__ void ml_seq(const Params& p, LAS unsigned char* lds, int wgi, int wave, int lane) {
    const int u = wgi * 2 + (wave >> 2), wi = wave & 3, h = u / 9, sl = u % 9, g = lane >> 4, c = lane & 15;
    LAS unsigned short* CT = (LAS unsigned short*)(lds + (wave >> 2) * 4096);
    float* HO = (float*)(p.ws + WS_HO); float* HDEN = (float*)(p.ws + WS_HDEN);
    const int offA = (16 * wi + c) * 64 + 8 * g, offV = (16 * sl + c) * 64 + 8 * g;
    *(LAS v2u*)(CT + c * 64 + 16 * wi + 4 * g) = (v2u){0u, 0u};
    pg8::f32x4 Cacc = {0.f, 0.f, 0.f, 0.f};
    __syncthreads();
    MlFrags F0, F1;
    ml_load(F0, p, h, offA, offV);
#define ML_STEP(F, n_) do { const int cur = (n_) & 1; \
        const bf16x8_t c0 = *(const LAS bf16x8_t*)(CT + cur * 1024 + c * 64 + 8 * g), c1 = *(const LAS bf16x8_t*)(CT + cur * 1024 + c * 64 + 32 + 8 * g); \
        pg8::f32x4 num = {0.f, 0.f, 0.f, 0.f}; \
        num = __builtin_amdgcn_mfma_f32_16x16x32_bf16(F.q[0], c0, num, 0, 0, 0); num = __builtin_amdgcn_mfma_f32_16x16x32_bf16(F.q[1], c1, num, 0, 0, 0); \
        num = __builtin_amdgcn_mfma_f32_16x16x32_bf16(F.s[0], F.vt[0], num, 0, 0, 0); num = __builtin_amdgcn_mfma_f32_16x16x32_bf16(F.s[1], F.vt[1], num, 0, 0, 0); \
        Cacc = Cacc * F.fl; \
        Cacc = __builtin_amdgcn_mfma_f32_16x16x32_bf16(F.kt[0], F.vt[0], Cacc, 0, 0, 0); Cacc = __builtin_amdgcn_mfma_f32_16x16x32_bf16(F.kt[1], F.vt[1], Cacc, 0, 0, 0); \
        { v2u w; w.x = pk2(Cacc[0], Cacc[1]); w.y = pk2(Cacc[2], Cacc[3]); *(LAS v2u*)(CT + (cur ^ 1) * 1024 + c * 64 + 16 * wi + 4 * g) = w; } \
        { const size_t tb = (size_t)(n_) * 64 + 16 * wi + 4 * g; \
          if (sl < 8) { _Pragma("unroll") for (int r = 0; r < 4; ++r) HO[(tb + r) * BW + h * 128 + 16 * sl + c] = num[r]; } \
          else if (c == 0) { _Pragma("unroll") for (int r = 0; r < 4; ++r) HDEN[(tb + r) * 4 + h] = num[r]; } } \
        __syncthreads(); } while (0)
    for (int n = 0; n < T / 64; n += 2) {
        ml_load(F1, p, (n + 1) * 4 + h, offA, offV);
        ML_STEP(F0, n);
        if (n + 2 < T / 64) ml_load(F0, p, (n + 2) * 4 + h, offA, offV);
        ML_STEP(F1, n + 1);
    }
#undef ML_STEP
}


constexpr int QP = 132;
__device__ __forceinline__ void gdn_pre_item(const Params& p, int l, LAS unsigned char* lds, int item, int tid, int wave, int lane) {
    const int h = item & 3, n = item >> 2; const size_t t0 = (size_t)n * 64;
    const bf16* Z = (const bf16*)(p.ws + WS_Z); const float* SMALL = (const float*)(p.ws + WS_SMALL);
    float* GU = (float*)(p.ws + WS_GU) + (size_t)item * 8192; bf16* GNW = (bf16*)(p.ws + WS_GNW) + (size_t)item * 8192; bf16* GQG = (bf16*)(p.ws + WS_GQG) + (size_t)item * 8192;
    bf16* GAT = (bf16*)(p.ws + WS_GAT) + (size_t)item * 4096; bf16* GKT = (bf16*)(p.ws + WS_GKT) + (size_t)item * 8192; float* GDL = (float*)(p.ws + WS_GDL);
    const float* cw = p.in[I_CONVW] + (size_t)l * 4 * 1536;
    LAS float* qs = (LAS float*)lds; LAS float* ks = qs + 64 * QP; LAS float* vs = ks + 64 * QP; LAS float* Ls = vs + 64 * QP;   LAS float* gcs = Ls + 64 * 68; LAS float* bts = gcs + 64; LAS float* btg = bts + 64;
    { const int tk = tid >> 3, part = tid & 7;
#pragma unroll 1
      for (int i = 0; i < 3; ++i) { float a[16];
#pragma unroll
        for (int x = 0; x < 16; ++x) a[x] = 0.f;
#pragma unroll
        for (int j = 0; j < 4; ++j) { const long tt = (long)t0 + tk - 3 + j; if (tt >= 0) {
            const bf16* src = Z + (size_t)tt * ZC + ZC_GDN + i * 512 + h * 128 + 16 * part; float x0[8], x1[8]; unpack8(*(const v4u*)src, x0); unpack8(*(const v4u*)(src + 8), x1);
            const float* wp = cw + j * 1536 + i * 512 + h * 128 + 16 * part;
#pragma unroll
            for (int x = 0; x < 8; ++x) { a[x] += wp[x] * x0[x]; a[8 + x] += wp[8 + x] * x1[x]; } } }
        float ss = 0.f;
#pragma unroll
        for (int x = 0; x < 16; ++x) { a[x] = siluf_(a[x]); ss += a[x] * a[x]; }
        if (i < 2) { ss = sum8(ss); const float r = rsqrtf(ss + 1e-6f) * (i == 0 ? 0.08838834764831845f : 1.f);
#pragma unroll
            for (int x = 0; x < 16; ++x) a[x] *= r; }
        LAS float* dst = (i == 0 ? qs : (i == 1 ? ks : vs)) + tk * QP + 16 * part;
#pragma unroll
        for (int x4 = 0; x4 < 4; ++x4) *(LAS v4f*)(dst + 4 * x4) = (v4f){a[4 * x4], a[4 * x4 + 1], a[4 * x4 + 2], a[4 * x4 + 3]}; } }
    if (wave == 0) { const float bb = SMALL[(t0 + lane) * 16 + h], aa = SMALL[(t0 + lane) * 16 + 4 + h];
        const float g = -__expf(p.in[I_ALOG][l * 4 + h]) * softplusf_(aa + p.in[I_DTB][l * 4 + h]);
        const float gc = wave_scan_incl(g), bt = sigmoidf_(bb); gcs[lane] = gc; bts[lane] = bt; btg[lane] = bt * __expf(gc); }
    __syncthreads();
    { const int i = tid >> 3, jb = tid & 7; const float gi = gcs[i], bi = bts[i]; float dk[8], dq[8];
#pragma unroll
      for (int x = 0; x < 8; ++x) { dk[x] = 0.f; dq[x] = 0.f; }
      if (8 * jb <= i) {
#pragma unroll 2
          for (int d4 = 0; d4 < 32; ++d4) { const v4f qi = *(const LAS v4f*)(qs + i * QP + 4 * d4), ki = *(const LAS v4f*)(ks + i * QP + 4 * d4);
#pragma unroll
              for (int x = 0; x < 8; ++x) { const v4f kj = *(const LAS v4f*)(ks + (8 * jb + x) * QP + 4 * d4);
                  dk[x] += ki.x * kj.x + ki.y * kj.y + ki.z * kj.z + ki.w * kj.w; dq[x] += qi.x * kj.x + qi.y * kj.y + qi.z * kj.z + qi.w * kj.w; } }
#pragma unroll
          for (int x = 0; x < 8; ++x) { const int j = 8 * jb + x; const float dc = __expf(gi - gcs[j]); dk[x] = (j < i) ? bi * dk[x] * dc : 0.f; dq[x] = (j <= i) ? dq[x] * dc : 0.f; } }
      *(LAS v4f*)(Ls + i * 68 + 8 * jb) = (v4f){dk[0], dk[1], dk[2], dk[3]}; *(LAS v4f*)(Ls + i * 68 + 8 * jb + 4) = (v4f){dk[4], dk[5], dk[6], dk[7]};
      v4u w; w.x = pk2(dq[0], dq[1]); w.y = pk2(dq[2], dq[3]); w.z = pk2(dq[4], dq[5]); w.w = pk2(dq[6], dq[7]); *(v4u*)(GAT + i * 64 + 8 * jb) = w; }
    __syncthreads();
    if (tid < 256) {
        const int c = tid; int vz; asm volatile("v_mov_b32 %0, 0" : "=v"(vz));
        const LAS float* rp = (c < 128) ? (vs + c) : (ks + (c - 128)); const LAS float* mp = ((c < 128) ? bts : btg) + vz;
#define GDN_RHS(i) (rp[(i) * QP] * mp[(i)])
#define GDN_L4(i, j4) (*(const LAS v4f*)(Ls + (i) * 68 + 4 * (j4) + vz))
        float x0 = GDN_RHS(0); __builtin_amdgcn_sched_barrier(0);
        float x1 = GDN_RHS(1); { const v4f l = GDN_L4(1, 0); x1 -= l.x * x0; } __builtin_amdgcn_sched_barrier(0);
        float x2 = GDN_RHS(2); { const v4f l = GDN_L4(2, 0); x2 -= l.x * x0; x2 -= l.y * x1; } __builtin_amdgcn_sched_barrier(0);
        float x3 = GDN_RHS(3); { const v4f l = GDN_L4(3, 0); x3 -= l.x * x0; x3 -= l.y * x1; x3 -= l.z * x2; } __builtin_amdgcn_sched_barrier(0);
        float x4 = GDN_RHS(4); { const v4f l = GDN_L4(4, 0); x4 -= l.x * x0; x4 -= l.y * x1; x4 -= l.z * x2; x4 -= l.w * x3; } __builtin_amdgcn_sched_barrier(0);
        float x5 = GDN_RHS(5); { const v4f l = GDN_L4(5, 0); x5 -= l.x * x0; x5 -= l.y * x1; x5 -= l.z * x2; x5 -= l.w * x3; } { const v4f l = GDN_L4(5, 1); x5 -= l.x * x4; } __builtin_amdgcn_sched_barrier(0);
        float x6 = GDN_RHS(6); { const v4f l = GDN_L4(6, 0); x6 -= l.x * x0; x6 -= l.y * x1; x6 -= l.z * x2; x6 -= l.w * x3; } { const v4f l = GDN_L4(6, 1); x6 -= l.x * x4; x6 -= l.y * x5; } __builtin_amdgcn_sched_barrier(0);
        float x7 = GDN_RHS(7); { const v4f l = GDN_L4(7, 0); x7 -= l.x * x0; x7 -= l.y * x1; x7 -= l.z * x2; x7 -= l.w * x3; } { const v4f l = GDN_L4(7, 1); x7 -= l.x * x4; x7 -= l.y * x5; x7 -= l.z * x6; } __builtin_amdgcn_sched_barrier(0);
        float x8 = GDN_RHS(8); { const v4f l = GDN_L4(8, 0); x8 -= l.x * x0; x8 -= l.y * x1; x8 -= l.z * x2; x8 -= l.w * x3; } { const v4f l = GDN_L4(8, 1); x8 -= l.x * x4; x8 -= l.y * x5; x8 -= l.z * x6; x8 -= l.w * x7; } __builtin_amdgcn_sched_barrier(0);
        float x9 = GDN_RHS(9); { const v4f l = GDN_L4(9, 0); x9 -= l.x * x0; x9 -= l.y * x1; x9 -= l.z * x2; x9 -= l.w * x3; } { const v4f l = GDN_L4(9, 1); x9 -= l.x * x4; x9 -= l.y * x5; x9 -= l.z * x6; x9 -= l.w * x7; } { const v4f l = GDN_L4(9, 2); x9 -= l.x * x8; } __builtin_amdgcn_sched_barrier(0);
        float x10 = GDN_RHS(10); { const v4f l = GDN_L4(10, 0); x10 -= l.x * x0; x10 -= l.y * x1; x10 -= l.z * x2; x10 -= l.w * x3; } { const v4f l = GDN_L4(10, 1); x10 -= l.x * x4; x10 -= l.y * x5; x10 -= l.z * x6; x10 -= l.w * x7; } { const v4f l = GDN_L4(10, 2); x10 -= l.x * x8; x10 -= l.y * x9; } __builtin_amdgcn_sched_barrier(0);
        float x11 = GDN_RHS(11); { const v4f l = GDN_L4(11, 0); x11 -= l.x * x0; x11 -= l.y * x1; x11 -= l.z * x2; x11 -= l.w * x3; } { const v4f l = GDN_L4(11, 1); x11 -= l.x * x4; x11 -= l.y * x5; x11 -= l.z * x6; x11 -= l.w * x7; } { const v4f l = GDN_L4(11, 2); x11 -= l.x * x8; x11 -= l.y * x9; x11 -= l.z * x10; } __builtin_amdgcn_sched_barrier(0);
        float x12 = GDN_RHS(12); { const v4f l = GDN_L4(12, 0); x12 -= l.x * x0; x12 -= l.y * x1; x12 -= l.z * x2; x12 -= l.w * x3; } { const v4f l = GDN_L4(12, 1); x12 -= l.x * x4; x12 -= l.y * x5; x12 -= l.z * x6; x12 -= l.w * x7; } { const v4f l = GDN_L4(12, 2); x12 -= l.x * x8; x12 -= l.y * x9; x12 -= l.z * x10; x12 -= l.w * x11; } __builtin_amdgcn_sched_barrier(0);
        float x13 = GDN_RHS(13); { const v4f l = GDN_L4(13, 0); x13 -= l.x * x0; x13 -= l.y * x1; x13 -= l.z * x2; x13 -= l.w * x3; } { const v4f l = GDN_L4(13, 1); x13 -= l.x * x4; x13 -= l.y * x5; x13 -= l.z * x6; x13 -= l.w * x7; } { const v4f l = GDN_L4(13, 2); x13 -= l.x * x8; x13 -= l.y * x9; x13 -= l.z * x10; x13 -= l.w * x11; } { const v4f l = GDN_L4(13, 3); x13 -= l.x * x12; } __builtin_amdgcn_sched_barrier(0);
        float x14 = GDN_RHS(14); { const v4f l = GDN_L4(14, 0); x14 -= l.x * x0; x14 -= l.y * x1; x14 -= l.z * x2; x14 -= l.w * x3; } { const v4f l = GDN_L4(14, 1); x14 -= l.x * x4; x14 -= l.y * x5; x14 -= l.z * x6; x14 -= l.w * x7; } { const v4f l = GDN_L4(14, 2); x14 -= l.x * x8; x14 -= l.y * x9; x14 -= l.z * x10; x14 -= l.w * x11; } { const v4f l = GDN_L4(14, 3); x14 -= l.x * x12; x14 -= l.y * x13; } __builtin_amdgcn_sched_barrier(0);
        float x15 = GDN_RHS(15); { const v4f l = GDN_L4(15, 0); x15 -= l.x * x0; x15 -= l.y * x1; x15 -= l.z * x2; x15 -= l.w * x3; } { const v4f l = GDN_L4(15, 1); x15 -= l.x * x4; x15 -= l.y * x5; x15 -= l.z * x6; x15 -= l.w * x7; } { const v4f l = GDN_L4(15, 2); x15 -= l.x * x8; x15 -= l.y * x9; x15 -= l.z * x10; x15 -= l.w * x11; } { const v4f l = GDN_L4(15, 3); x15 -= l.x * x12; x15 -= l.y * x13; x15 -= l.z * x14; } __builtin_amdgcn_sched_barrier(0);
        float x16 = GDN_RHS(16); { const v4f l = GDN_L4(16, 0); x16 -= l.x * x0; x16 -= l.y * x1; x16 -= l.z * x2; x16 -= l.w * x3; } { const v4f l = GDN_L4(16, 1); x16 -= l.x * x4; x16 -= l.y * x5; x16 -= l.z * x6; x16 -= l.w * x7; } { const v4f l = GDN_L4(16, 2); x16 -= l.x * x8; x16 -= l.y * x9; x16 -= l.z * x10; x16 -= l.w * x11; } { const v4f l = GDN_L4(16, 3); x16 -= l.x * x12; x16 -= l.y * x13; x16 -= l.z * x14; x16 -= l.w * x15; } __builtin_amdgcn_sched_barrier(0);
        float x17 = GDN_RHS(17); { const v4f l = GDN_L4(17, 0); x17 -= l.x * x0; x17 -= l.y * x1; x17 -= l.z * x2; x17 -= l.w * x3; } { const v4f l = GDN_L4(17, 1); x17 -= l.x * x4; x17 -= l.y * x5; x17 -= l.z * x6; x17 -= l.w * x7; } { const v4f l = GDN_L4(17, 2); x17 -= l.x * x8; x17 -= l.y * x9; x17 -= l.z * x10; x17 -= l.w * x11; } { const v4f l = GDN_L4(17, 3); x17 -= l.x * x12; x17 -= l.y * x13; x17 -= l.z * x14; x17 -= l.w * x15; } { const v4f l = GDN_L4(17, 4); x17 -= l.x * x16; } __builtin_amdgcn_sched_barrier(0);
        float x18 = GDN_RHS(18); { const v4f l = GDN_L4(18, 0); x18 -= l.x * x0; x18 -= l.y * x1; x18 -= l.z * x2; x18 -= l.w * x3; } { const v4f l = GDN_L4(18, 1); x18 -= l.x * x4; x18 -= l.y * x5; x18 -= l.z * x6; x18 -= l.w * x7; } { const v4f l = GDN_L4(18, 2); x18 -= l.x * x8; x18 -= l.y * x9; x18 -= l.z * x10; x18 -= l.w * x11; } { const v4f l = GDN_L4(18, 3); x18 -= l.x * x12; x18 -= l.y * x13; x18 -= l.z * x14; x18 -= l.w * x15; } { const v4f l = GDN_L4(18, 4); x18 -= l.x * x16; x18 -= l.y * x17; } __builtin_amdgcn_sched_barrier(0);
        float x19 = GDN_RHS(19); { const v4f l = GDN_L4(19, 0); x19 -= l.x * x0; x19 -= l.y * x1; x19 -= l.z * x2; x19 -= l.w * x3; } { const v4f l = GDN_L4(19, 1); x19 -= l.x * x4; x19 -= l.y * x5; x19 -= l.z * x6; x19 -= l.w * x7; } { const v4f l = GDN_L4(19, 2); x19 -= l.x * x8; x19 -= l.y * x9; x19 -= l.z * x10; x19 -= l.w * x11; } { const v4f l = GDN_L4(19, 3); x19 -= l.x * x12; x19 -= l.y * x13; x19 -= l.z * x14; x19 -= l.w * x15; } { const v4f l = GDN_L4(19, 4); x19 -= l.x * x16; x19 -= l.y * x17; x19 -= l.z * x18; } __builtin_amdgcn_sched_barrier(0);
        float x20 = GDN_RHS(20); { const v4f l = GDN_L4(20, 0); x20 -= l.x * x0; x20 -= l.y * x1; x20 -= l.z * x2; x20 -= l.w * x3; } { const v4f l = GDN_L4(20, 1); x20 -= l.x * x4; x20 -= l.y * x5; x20 -= l.z * x6; x20 -= l.w * x7; } { const v4f l = GDN_L4(20, 2); x20 -= l.x * x8; x20 -= l.y * x9; x20 -= l.z * x10; x20 -= l.w * x11; } { const v4f l = GDN_L4(20, 3); x20 -= l.x * x12; x20 -= l.y * x13; x20 -= l.z * x14; x20 -= l.w * x15; } { const v4f l = GDN_L4(20, 4); x20 -= l.x * x16; x20 -= l.y * x17; x20 -= l.z * x18; x20 -= l.w * x19; } __builtin_amdgcn_sched_barrier(0);
        float x21 = GDN_RHS(21); { const v4f l = GDN_L4(21, 0); x21 -= l.x * x0; x21 -= l.y * x1; x21 -= l.z * x2; x21 -= l.w * x3; } { const v4f l = GDN_L4(21, 1); x21 -= l.x * x4; x21 -= l.y * x5; x21 -= l.z * x6; x21 -= l.w * x7; } { const v4f l = GDN_L4(21, 2); x21 -= l.x * x8; x21 -= l.y * x9; x21 -= l.z * x10; x21 -= l.w * x11; } { const v4f l = GDN_L4(21, 3); x21 -= l.x * x12; x21 -= l.y * x13; x21 -= l.z * x14; x21 -= l.w * x15; } { const v4f l = GDN_L4(21, 4); x21 -= l.x * x16; x21 -= l.y * x17; x21 -= l.z * x18; x21 -= l.w * x19; } { const v4f l = GDN_L4(21, 5); x21 -= l.x * x20; } __builtin_amdgcn_sched_barrier(0);
        float x22 = GDN_RHS(22); { const v4f l = GDN_L4(22, 0); x22 -= l.x * x0; x22 -= l.y * x1; x22 -= l.z * x2; x22 -= l.w * x3; } { const v4f l = GDN_L4(22, 1); x22 -= l.x * x4; x22 -= l.y * x5; x22 -= l.z * x6; x22 -= l.w * x7; } { const v4f l = GDN_L4(22, 2); x22 -= l.x * x8; x22 -= l.y * x9; x22 -= l.z * x10; x22 -= l.w * x11; } { const v4f l = GDN_L4(22, 3); x22 -= l.x * x12; x22 -= l.y * x13; x22 -= l.z * x14; x22 -= l.w * x15; } { const v4f l = GDN_L4(22, 4); x22 -= l.x * x16; x22 -= l.y * x17; x22 -= l.z * x18; x22 -= l.w * x19; } { const v4f l = GDN_L4(22, 5); x22 -= l.x * x20; x22 -= l.y * x21; } __builtin_amdgcn_sched_barrier(0);
        float x23 = GDN_RHS(23); { const v4f l = GDN_L4(23, 0); x23 -= l.x * x0; x23 -= l.y * x1; x23 -= l.z * x2; x23 -= l.w * x3; } { const v4f l = GDN_L4(23, 1); x23 -= l.x * x4; x23 -= l.y * x5; x23 -= l.z * x6; x23 -= l.w * x7; } { const v4f l = GDN_L4(23, 2); x23 -= l.x * x8; x23 -= l.y * x9; x23 -= l.z * x10; x23 -= l.w * x11; } { const v4f l = GDN_L4(23, 3); x23 -= l.x * x12; x23 -= l.y * x13; x23 -= l.z * x14; x23 -= l.w * x15; } { const v4f l = GDN_L4(23, 4); x23 -= l.x * x16; x23 -= l.y * x17; x23 -= l.z * x18; x23 -= l.w * x19; } { const v4f l = GDN_L4(23, 5); x23 -= l.x * x20; x23 -= l.y * x21; x23 -= l.z * x22; } __builtin_amdgcn_sched_barrier(0);
        float x24 = GDN_RHS(24); { const v4f l = GDN_L4(24, 0); x24 -= l.x * x0; x24 -= l.y * x1; x24 -= l.z * x2; x24 -= l.w * x3; } { const v4f l = GDN_L4(24, 1); x24 -= l.x * x4; x24 -= l.y * x5; x24 -= l.z * x6; x24 -= l.w * x7; } { const v4f l = GDN_L4(24, 2); x24 -= l.x * x8; x24 -= l.y * x9; x24 -= l.z * x10; x24 -= l.w * x11; } { const v4f l = GDN_L4(24, 3); x24 -= l.x * x12; x24 -= l.y * x13; x24 -= l.z * x14; x24 -= l.w * x15; } { const v4f l = GDN_L4(24, 4); x24 -= l.x * x16; x24 -= l.y * x17; x24 -= l.z * x18; x24 -= l.w * x19; } { const v4f l = GDN_L4(24, 5); x24 -= l.x * x20; x24 -= l.y * x21; x24 -= l.z * x22; x24 -= l.w * x23; } __builtin_amdgcn_sched_barrier(0);
        float x25 = GDN_RHS(25); { const v4f l = GDN_L4(25, 0); x25 -= l.x * x0; x25 -= l.y * x1; x25 -= l.z * x2; x25 -= l.w * x3; } { const v4f l = GDN_L4(25, 1); x25 -= l.x * x4; x25 -= l.y * x5; x25 -= l.z * x6; x25 -= l.w * x7; } { const v4f l = GDN_L4(25, 2); x25 -= l.x * x8; x25 -= l.y * x9; x25 -= l.z * x10; x25 -= l.w * x11; } { const v4f l = GDN_L4(25, 3); x25 -= l.x * x12; x25 -= l.y * x13; x25 -= l.z * x14; x25 -= l.w * x15; } { const v4f l = GDN_L4(25, 4); x25 -= l.x * x16; x25 -= l.y * x17; x25 -= l.z * x18; x25 -= l.w * x19; } { const v4f l = GDN_L4(25, 5); x25 -= l.x * x20; x25 -= l.y * x21; x25 -= l.z * x22; x25 -= l.w * x23; } { const v4f l = GDN_L4(25, 6); x25 -= l.x * x24; } __builtin_amdgcn_sched_barrier(0);
        float x26 = GDN_RHS(26); { const v4f l = GDN_L4(26, 0); x26 -= l.x * x0; x26 -= l.y * x1; x26 -= l.z * x2; x26 -= l.w * x3; } { const v4f l = GDN_L4(26, 1); x26 -= l.x * x4; x26 -= l.y * x5; x26 -= l.z * x6; x26 -= l.w * x7; } { const v4f l = GDN_L4(26, 2); x26 -= l.x * x8; x26 -= l.y * x9; x26 -= l.z * x10; x26 -= l.w * x11; } { const v4f l = GDN_L4(26, 3); x26 -= l.x * x12; x26 -= l.y * x13; x26 -= l.z * x14; x26 -= l.w * x15; } { const v4f l = GDN_L4(26, 4); x26 -= l.x * x16; x26 -= l.y * x17; x26 -= l.z * x18; x26 -= l.w * x19; } { const v4f l = GDN_L4(26, 5); x26 -= l.x * x20; x26 -= l.y * x21; x26 -= l.z * x22; x26 -= l.w * x23; } { const v4f l = GDN_L4(26, 6); x26 -= l.x * x24; x26 -= l.y * x25; } __builtin_amdgcn_sched_barrier(0);
        float x27 = GDN_RHS(27); { const v4f l = GDN_L4(27, 0); x27 -= l.x * x0; x27 -= l.y * x1; x27 -= l.z * x2; x27 -= l.w * x3; } { const v4f l = GDN_L4(27, 1); x27 -= l.x * x4; x27 -= l.y * x5; x27 -= l.z * x6; x27 -= l.w * x7; } { const v4f l = GDN_L4(27, 2); x27 -= l.x * x8; x27 -= l.y * x9; x27 -= l.z * x10; x27 -= l.w * x11; } { const v4f l = GDN_L4(27, 3); x27 -= l.x * x12; x27 -= l.y * x13; x27 -= l.z * x14; x27 -= l.w * x15; } { const v4f l = GDN_L4(27, 4); x27 -= l.x * x16; x27 -= l.y * x17; x27 -= l.z * x18; x27 -= l.w * x19; } { const v4f l = GDN_L4(27, 5); x27 -= l.x * x20; x27 -= l.y * x21; x27 -= l.z * x22; x27 -= l.w * x23; } { const v4f l = GDN_L4(27, 6); x27 -= l.x * x24; x27 -= l.y * x25; x27 -= l.z * x26; } __builtin_amdgcn_sched_barrier(0);
        float x28 = GDN_RHS(28); { const v4f l = GDN_L4(28, 0); x28 -= l.x * x0; x28 -= l.y * x1; x28 -= l.z * x2; x28 -= l.w * x3; } { const v4f l = GDN_L4(28, 1); x28 -= l.x * x4; x28 -= l.y * x5; x28 -= l.z * x6; x28 -= l.w * x7; } { const v4f l = GDN_L4(28, 2); x28 -= l.x * x8; x28 -= l.y * x9; x28 -= l.z * x10; x28 -= l.w * x11; } { const v4f l = GDN_L4(28, 3); x28 -= l.x * x12; x28 -= l.y * x13; x28 -= l.z * x14; x28 -= l.w * x15; } { const v4f l = GDN_L4(28, 4); x28 -= l.x * x16; x28 -= l.y * x17; x28 -= l.z * x18; x28 -= l.w * x19; } { const v4f l = GDN_L4(28, 5); x28 -= l.x * x20; x28 -= l.y * x21; x28 -= l.z * x22; x28 -= l.w * x23; } { const v4f l = GDN_L4(28, 6); x28 -= l.x * x24; x28 -= l.y * x25; x28 -= l.z * x26; x28 -= l.w * x27; } __builtin_amdgcn_sched_barrier(0);
        float x29 = GDN_RHS(29); { const v4f l = GDN_L4(29, 0); x29 -= l.x * x0; x29 -= l.y * x1; x29 -= l.z * x2; x29 -= l.w * x3; } { const v4f l = GDN_L4(29, 1); x29 -= l.x * x4; x29 -= l.y * x5; x29 -= l.z * x6; x29 -= l.w * x7; } { const v4f l = GDN_L4(29, 2); x29 -= l.x * x8; x29 -= l.y * x9; x29 -= l.z * x10; x29 -= l.w * x11; } { const v4f l = GDN_L4(29, 3); x29 -= l.x * x12; x29 -= l.y * x13; x29 -= l.z * x14; x29 -= l.w * x15; } { const v4f l = GDN_L4(29, 4); x29 -= l.x * x16; x29 -= l.y * x17; x29 -= l.z * x18; x29 -= l.w * x19; } { const v4f l = GDN_L4(29, 5); x29 -= l.x * x20; x29 -= l.y * x21; x29 -= l.z * x22; x29 -= l.w * x23; } { const v4f l = GDN_L4(29, 6); x29 -= l.x * x24; x29 -= l.y * x25; x29 -= l.z * x26; x29 -= l.w * x27; } { const v4f l = GDN_L4(29, 7); x29 -= l.x * x28; } __builtin_amdgcn_sched_barrier(0);
        float x30 = GDN_RHS(30); { const v4f l = GDN_L4(30, 0); x30 -= l.x * x0; x30 -= l.y * x1; x30 -= l.z * x2; x30 -= l.w * x3; } { const v4f l = GDN_L4(30, 1); x30 -= l.x * x4; x30 -= l.y * x5; x30 -= l.z * x6; x30 -= l.w * x7; } { const v4f l = GDN_L4(30, 2); x30 -= l.x * x8; x30 -= l.y * x9; x30 -= l.z * x10; x30 -= l.w * x11; } { const v4f l = GDN_L4(30, 3); x30 -= l.x * x12; x30 -= l.y * x13; x30 -= l.z * x14; x30 -= l.w * x15; } { const v4f l = GDN_L4(30, 4); x30 -= l.x * x16; x30 -= l.y * x17; x30 -= l.z * x18; x30 -= l.w * x19; } { const v4f l = GDN_L4(30, 5); x30 -= l.x * x20; x30 -= l.y * x21; x30 -= l.z * x22; x30 -= l.w * x23; } { const v4f l = GDN_L4(30, 6); x30 -= l.x * x24; x30 -= l.y * x25; x30 -= l.z * x26; x30 -= l.w * x27; } { const v4f l = GDN_L4(30, 7); x30 -= l.x * x28; x30 -= l.y * x29; } __builtin_amdgcn_sched_barrier(0);
        float x31 = GDN_RHS(31); { const v4f l = GDN_L4(31, 0); x31 -= l.x * x0; x31 -= l.y * x1; x31 -= l.z * x2; x31 -= l.w * x3; } { const v4f l = GDN_L4(31, 1); x31 -= l.x * x4; x31 -= l.y * x5; x31 -= l.z * x6; x31 -= l.w * x7; } { const v4f l = GDN_L4(31, 2); x31 -= l.x * x8; x31 -= l.y * x9; x31 -= l.z * x10; x31 -= l.w * x11; } { const v4f l = GDN_L4(31, 3); x31 -= l.x * x12; x31 -= l.y * x13; x31 -= l.z * x14; x31 -= l.w * x15; } { const v4f l = GDN_L4(31, 4); x31 -= l.x * x16; x31 -= l.y * x17; x31 -= l.z * x18; x31 -= l.w * x19; } { const v4f l = GDN_L4(31, 5); x31 -= l.x * x20; x31 -= l.y * x21; x31 -= l.z * x22; x31 -= l.w * x23; } { const v4f l = GDN_L4(31, 6); x31 -= l.x * x24; x31 -= l.y * x25; x31 -= l.z * x26; x31 -= l.w * x27; } { const v4f l = GDN_L4(31, 7); x31 -= l.x * x28; x31 -= l.y * x29; x31 -= l.z * x30; } __builtin_amdgcn_sched_barrier(0);
        float x32 = GDN_RHS(32); { const v4f l = GDN_L4(32, 0); x32 -= l.x * x0; x32 -= l.y * x1; x32 -= l.z * x2; x32 -= l.w * x3; } { const v4f l = GDN_L4(32, 1); x32 -= l.x * x4; x32 -= l.y * x5; x32 -= l.z * x6; x32 -= l.w * x7; } { const v4f l = GDN_L4(32, 2); x32 -= l.x * x8; x32 -= l.y * x9; x32 -= l.z * x10; x32 -= l.w * x11; } { const v4f l = GDN_L4(32, 3); x32 -= l.x * x12; x32 -= l.y * x13; x32 -= l.z * x14; x32 -= l.w * x15; } { const v4f l = GDN_L4(32, 4); x32 -= l.x * x16; x32 -= l.y * x17; x32 -= l.z * x18; x32 -= l.w * x19; } { const v4f l = GDN_L4(32, 5); x32 -= l.x * x20; x32 -= l.y * x21; x32 -= l.z * x22; x32 -= l.w * x23; } { const v4f l = GDN_L4(32, 6); x32 -= l.x * x24; x32 -= l.y * x25; x32 -= l.z * x26; x32 -= l.w * x27; } { const v4f l = GDN_L4(32, 7); x32 -= l.x * x28; x32 -= l.y * x29; x32 -= l.z * x30; x32 -= l.w * x31; } __builtin_amdgcn_sched_barrier(0);
        float x33 = GDN_RHS(33); { const v4f l = GDN_L4(33, 0); x33 -= l.x * x0; x33 -= l.y * x1; x33 -= l.z * x2; x33 -= l.w * x3; } { const v4f l = GDN_L4(33, 1); x33 -= l.x * x4; x33 -= l.y * x5; x33 -= l.z * x6; x33 -= l.w * x7; } { const v4f l = GDN_L4(33, 2); x33 -= l.x * x8; x33 -= l.y * x9; x33 -= l.z * x10; x33 -= l.w * x11; } { const v4f l = GDN_L4(33, 3); x33 -= l.x * x12; x33 -= l.y * x13; x33 -= l.z * x14; x33 -= l.w * x15; } { const v4f l = GDN_L4(33, 4); x33 -= l.x * x16; x33 -= l.y * x17; x33 -= l.z * x18; x33 -= l.w * x19; } { const v4f l = GDN_L4(33, 5); x33 -= l.x * x20; x33 -= l.y * x21; x33 -= l.z * x22; x33 -= l.w * x23; } { const v4f l = GDN_L4(33, 6); x33 -= l.x * x24; x33 -= l.y * x25; x33 -= l.z * x26; x33 -= l.w * x27; } { const v4f l = GDN_L4(33, 7); x33 -= l.x * x28; x33 -= l.y * x29; x33 -= l.z * x30; x33 -= l.w * x31; } { const v4f l = GDN_L4(33, 8); x33 -= l.x * x32; } __builtin_amdgcn_sched_barrier(0);
        float x34 = GDN_RHS(34); { const v4f l = GDN_L4(34, 0); x34 -= l.x * x0; x34 -= l.y * x1; x34 -= l.z * x2; x34 -= l.w * x3; } { const v4f l = GDN_L4(34, 1); x34 -= l.x * x4; x34 -= l.y * x5; x34 -= l.z * x6; x34 -= l.w * x7; } { const v4f l = GDN_L4(34, 2); x34 -= l.x * x8; x34 -= l.y * x9; x34 -= l.z * x10; x34 -= l.w * x11; } { const v4f l = GDN_L4(34, 3); x34 -= l.x * x12; x34 -= l.y * x13; x34 -= l.z * x14; x34 -= l.w * x15; } { const v4f l = GDN_L4(34, 4); x34 -= l.x * x16; x34 -= l.y * x17; x34 -= l.z * x18; x34 -= l.w * x19; } { const v4f l = GDN_L4(34, 5); x34 -= l.x * x20; x34 -= l.y * x21; x34 -= l.z * x22; x34 -= l.w * x23; } { const v4f l = GDN_L4(34, 6); x34 -= l.x * x24; x34 -= l.y * x25; x34 -= l.z * x26; x34 -= l.w * x27; } { const v4f l = GDN_L4(34, 7); x34 -= l.x * x28; x34 -= l.y * x29; x34 -= l.z * x30; x34 -= l.w * x31; } { const v4f l = GDN_L4(34, 8); x34 -= l.x * x32; x34 -= l.y * x33; } __builtin_amdgcn_sched_barrier(0);
        float x35 = GDN_RHS(35); { const v4f l = GDN_L4(35, 0); x35 -= l.x * x0; x35 -= l.y * x1; x35 -= l.z * x2; x35 -= l.w * x3; } { const v4f l = GDN_L4(35, 1); x35 -= l.x * x4; x35 -= l.y * x5; x35 -= l.z * x6; x35 -= l.w * x7; } { const v4f l = GDN_L4(35, 2); x35 -= l.x * x8; x35 -= l.y * x9; x35 -= l.z * x10; x35 -= l.w * x11; } { const v4f l = GDN_L4(35, 3); x35 -= l.x * x12; x35 -= l.y * x13; x35 -= l.z * x14; x35 -= l.w * x15; } { const v4f l = GDN_L4(35, 4); x35 -= l.x * x16; x35 -= l.y * x17; x35 -= l.z * x18; x35 -= l.w * x19; } { const v4f l = GDN_L4(35, 5); x35 -= l.x * x20; x35 -= l.y * x21; x35 -= l.z * x22; x35 -= l.w * x23; } { const v4f l = GDN_L4(35, 6); x35 -= l.x * x24; x35 -= l.y * x25; x35 -= l.z * x26; x35 -= l.w * x27; } { const v4f l = GDN_L4(35, 7); x35 -= l.x * x28; x35 -= l.y * x29; x35 -= l.z * x30; x35 -= l.w * x31; } { const v4f l = GDN_L4(35, 8); x35 -= l.x * x32; x35 -= l.y * x33; x35 -= l.z * x34; } __builtin_amdgcn_sched_barrier(0);
        float x36 = GDN_RHS(36); { const v4f l = GDN_L4(36, 0); x36 -= l.x * x0; x36 -= l.y * x1; x36 -= l.z * x2; x36 -= l.w * x3; } { const v4f l = GDN_L4(36, 1); x36 -= l.x * x4; x36 -= l.y * x5; x36 -= l.z * x6; x36 -= l.w * x7; } { const v4f l = GDN_L4(36, 2); x36 -= l.x * x8; x36 -= l.y * x9; x36 -= l.z * x10; x36 -= l.w * x11; } { const v4f l = GDN_L4(36, 3); x36 -= l.x * x12; x36 -= l.y * x13; x36 -= l.z * x14; x36 -= l.w * x15; } { const v4f l = GDN_L4(36, 4); x36 -= l.x * x16; x36 -= l.y * x17; x36 -= l.z * x18; x36 -= l.w * x19; } { const v4f l = GDN_L4(36, 5); x36 -= l.x * x20; x36 -= l.y * x21; x36 -= l.z * x22; x36 -= l.w * x23; } { const v4f l = GDN_L4(36, 6); x36 -= l.x * x24; x36 -= l.y * x25; x36 -= l.z * x26; x36 -= l.w * x27; } { const v4f l = GDN_L4(36, 7); x36 -= l.x * x28; x36 -= l.y * x29; x36 -= l.z * x30; x36 -= l.w * x31; } { const v4f l = GDN_L4(36, 8); x36 -= l.x * x32; x36 -= l.y * x33; x36 -= l.z * x34; x36 -= l.w * x35; } __builtin_amdgcn_sched_barrier(0);
        float x37 = GDN_RHS(37); { const v4f l = GDN_L4(37, 0); x37 -= l.x * x0; x37 -= l.y * x1; x37 -= l.z * x2; x37 -= l.w * x3; } { const v4f l = GDN_L4(37, 1); x37 -= l.x * x4; x37 -= l.y * x5; x37 -= l.z * x6; x37 -= l.w * x7; } { const v4f l = GDN_L4(37, 2); x37 -= l.x * x8; x37 -= l.y * x9; x37 -= l.z * x10; x37 -= l.w * x11; } { const v4f l = GDN_L4(37, 3); x37 -= l.x * x12; x37 -= l.y * x13; x37 -= l.z * x14; x37 -= l.w * x15; } { const v4f l = GDN_L4(37, 4); x37 -= l.x * x16; x37 -= l.y * x17; x37 -= l.z * x18; x37 -= l.w * x19; } { const v4f l = GDN_L4(37, 5); x37 -= l.x * x20; x37 -= l.y * x21; x37 -= l.z * x22; x37 -= l.w * x23; } { const v4f l = GDN_L4(37, 6); x37 -= l.x * x24; x37 -= l.y * x25; x37 -= l.z * x26; x37 -= l.w * x27; } { const v4f l = GDN_L4(37, 7); x37 -= l.x * x28; x37 -= l.y * x29; x37 -= l.z * x30; x37 -= l.w * x31; } { const v4f l = GDN_L4(37, 8); x37 -= l.x * x32; x37 -= l.y * x33; x37 -= l.z * x34; x37 -= l.w * x35; } { const v4f l = GDN_L4(37, 9); x37 -= l.x * x36; } __builtin_amdgcn_sched_barrier(0);
        float x38 = GDN_RHS(38); { const v4f l = GDN_L4(38, 0); x38 -= l.x * x0; x38 -= l.y * x1; x38 -= l.z * x2; x38 -= l.w * x3; } { const v4f l = GDN_L4(38, 1); x38 -= l.x * x4; x38 -= l.y * x5; x38 -= l.z * x6; x38 -= l.w * x7; } { const v4f l = GDN_L4(38, 2); x38 -= l.x * x8; x38 -= l.y * x9; x38 -= l.z * x10; x38 -= l.w * x11; } { const v4f l = GDN_L4(38, 3); x38 -= l.x * x12; x38 -= l.y * x13; x38 -= l.z * x14; x38 -= l.w * x15; } { const v4f l = GDN_L4(38, 4); x38 -= l.x * x16; x38 -= l.y * x17; x38 -= l.z * x18; x38 -= l.w * x19; } { const v4f l = GDN_L4(38, 5); x38 -= l.x * x20; x38 -= l.y * x21; x38 -= l.z * x22; x38 -= l.w * x23; } { const v4f l = GDN_L4(38, 6); x38 -= l.x * x24; x38 -= l.y * x25; x38 -= l.z * x26; x38 -= l.w * x27; } { const v4f l = GDN_L4(38, 7); x38 -= l.x * x28; x38 -= l.y * x29; x38 -= l.z * x30; x38 -= l.w * x31; } { const v4f l = GDN_L4(38, 8); x38 -= l.x * x32; x38 -= l.y * x33; x38 -= l.z * x34; x38 -= l.w * x35; } { const v4f l = GDN_L4(38, 9); x38 -= l.x * x36; x38 -= l.y * x37; } __builtin_amdgcn_sched_barrier(0);
        float x39 = GDN_RHS(39); { const v4f l = GDN_L4(39, 0); x39 -= l.x * x0; x39 -= l.y * x1; x39 -= l.z * x2; x39 -= l.w * x3; } { const v4f l = GDN_L4(39, 1); x39 -= l.x * x4; x39 -= l.y * x5; x39 -= l.z * x6; x39 -= l.w * x7; } { const v4f l = GDN_L4(39, 2); x39 -= l.x * x8; x39 -= l.y * x9; x39 -= l.z * x10; x39 -= l.w * x11; } { const v4f l = GDN_L4(39, 3); x39 -= l.x * x12; x39 -= l.y * x13; x39 -= l.z * x14; x39 -= l.w * x15; } { const v4f l = GDN_L4(39, 4); x39 -= l.x * x16; x39 -= l.y * x17; x39 -= l.z * x18; x39 -= l.w * x19; } { const v4f l = GDN_L4(39, 5); x39 -= l.x * x20; x39 -= l.y * x21; x39 -= l.z * x22; x39 -= l.w * x23; } { const v4f l = GDN_L4(39, 6); x39 -= l.x * x24; x39 -= l.y * x25; x39 -= l.z * x26; x39 -= l.w * x27; } { const v4f l = GDN_L4(39, 7); x39 -= l.x * x28; x39 -= l.y * x29; x39 -= l.z * x30; x39 -= l.w * x31; } { const v4f l = GDN_L4(39, 8); x39 -= l.x * x32; x39 -= l.y * x33; x39 -= l.z * x34; x39 -= l.w * x35; } { const v4f l = GDN_L4(39, 9); x39 -= l.x * x36; x39 -= l.y * x37; x39 -= l.z * x38; } __builtin_amdgcn_sched_barrier(0);
        float x40 = GDN_RHS(40); { const v4f l = GDN_L4(40, 0); x40 -= l.x * x0; x40 -= l.y * x1; x40 -= l.z * x2; x40 -= l.w * x3; } { const v4f l = GDN_L4(40, 1); x40 -= l.x * x4; x40 -= l.y * x5; x40 -= l.z * x6; x40 -= l.w * x7; } { const v4f l = GDN_L4(40, 2); x40 -= l.x * x8; x40 -= l.y * x9; x40 -= l.z * x10; x40 -= l.w * x11; } { const v4f l = GDN_L4(40, 3); x40 -= l.x * x12; x40 -= l.y * x13; x40 -= l.z * x14; x40 -= l.w * x15; } { const v4f l = GDN_L4(40, 4); x40 -= l.x * x16; x40 -= l.y * x17; x40 -= l.z * x18; x40 -= l.w * x19; } { const v4f l = GDN_L4(40, 5); x40 -= l.x * x20; x40 -= l.y * x21; x40 -= l.z * x22; x40 -= l.w * x23; } { const v4f l = GDN_L4(40, 6); x40 -= l.x * x24; x40 -= l.y * x25; x40 -= l.z * x26; x40 -= l.w * x27; } { const v4f l = GDN_L4(40, 7); x40 -= l.x * x28; x40 -= l.y * x29; x40 -= l.z * x30; x40 -= l.w * x31; } { const v4f l = GDN_L4(40, 8); x40 -= l.x * x32; x40 -= l.y * x33; x40 -= l.z * x34; x40 -= l.w * x35; } { const v4f l = GDN_L4(40, 9); x40 -= l.x * x36; x40 -= l.y * x37; x40 -= l.z * x38; x40 -= l.w * x39; } __builtin_amdgcn_sched_barrier(0);
        float x41 = GDN_RHS(41); { const v4f l = GDN_L4(41, 0); x41 -= l.x * x0; x41 -= l.y * x1; x41 -= l.z * x2; x41 -= l.w * x3; } { const v4f l = GDN_L4(41, 1); x41 -= l.x * x4; x41 -= l.y * x5; x41 -= l.z * x6; x41 -= l.w * x7; } { const v4f l = GDN_L4(41, 2); x41 -= l.x * x8; x41 -= l.y * x9; x41 -= l.z * x10; x41 -= l.w * x11; } { const v4f l = GDN_L4(41, 3); x41 -= l.x * x12; x41 -= l.y * x13; x41 -= l.z * x14; x41 -= l.w * x15; } { const v4f l = GDN_L4(41, 4); x41 -= l.x * x16; x41 -= l.y * x17; x41 -= l.z * x18; x41 -= l.w * x19; } { const v4f l = GDN_L4(41, 5); x41 -= l.x * x20; x41 -= l.y * x21; x41 -= l.z * x22; x41 -= l.w * x23; } { const v4f l = GDN_L4(41, 6); x41 -= l.x * x24; x41 -= l.y * x25; x41 -= l.z * x26; x41 -= l.w * x27; } { const v4f l = GDN_L4(41, 7); x41 -= l.x * x28; x41 -= l.y * x29; x41 -= l.z * x30; x41 -= l.w * x31; } { const v4f l = GDN_L4(41, 8); x41 -= l.x * x32; x41 -= l.y * x33; x41 -= l.z * x34; x41 -= l.w * x35; } { const v4f l = GDN_L4(41, 9); x41 -= l.x * x36; x41 -= l.y * x37; x41 -= l.z * x38; x41 -= l.w * x39; } { const v4f l = GDN_L4(41, 10); x41 -= l.x * x40; } __builtin_amdgcn_sched_barrier(0);
        float x42 = GDN_RHS(42); { const v4f l = GDN_L4(42, 0); x42 -= l.x * x0; x42 -= l.y * x1; x42 -= l.z * x2; x42 -= l.w * x3; } { const v4f l = GDN_L4(42, 1); x42 -= l.x * x4; x42 -= l.y * x5; x42 -= l.z * x6; x42 -= l.w * x7; } { const v4f l = GDN_L4(42, 2); x42 -= l.x * x8; x42 -= l.y * x9; x42 -= l.z * x10; x42 -= l.w * x11; } { const v4f l = GDN_L4(42, 3); x42 -= l.x * x12; x42 -= l.y * x13; x42 -= l.z * x14; x42 -= l.w * x15; } { const v4f l = GDN_L4(42, 4); x42 -= l.x * x16; x42 -= l.y * x17; x42 -= l.z * x18; x42 -= l.w * x19; } { const v4f l = GDN_L4(42, 5); x42 -= l.x * x20; x42 -= l.y * x21; x42 -= l.z * x22; x42 -= l.w * x23; } { const v4f l = GDN_L4(42, 6); x42 -= l.x * x24; x42 -= l.y * x25; x42 -= l.z * x26; x42 -= l.w * x27; } { const v4f l = GDN_L4(42, 7); x42 -= l.x * x28; x42 -= l.y * x29; x42 -= l.z * x30; x42 -= l.w * x31; } { const v4f l = GDN_L4(42, 8); x42 -= l.x * x32; x42 -= l.y * x33; x42 -= l.z * x34; x42 -= l.w * x35; } { const v4f l = GDN_L4(42, 9); x42 -= l.x * x36; x42 -= l.y * x37; x42 -= l.z * x38; x42 -= l.w * x39; } { const v4f l = GDN_L4(42, 10); x42 -= l.x * x40; x42 -= l.y * x41; } __builtin_amdgcn_sched_barrier(0);
        float x43 = GDN_RHS(43); { const v4f l = GDN_L4(43, 0); x43 -= l.x * x0; x43 -= l.y * x1; x43 -= l.z * x2; x43 -= l.w * x3; } { const v4f l = GDN_L4(43, 1); x43 -= l.x * x4; x43 -= l.y * x5; x43 -= l.z * x6; x43 -= l.w * x7; } { const v4f l = GDN_L4(43, 2); x43 -= l.x * x8; x43 -= l.y * x9; x43 -= l.z * x10; x43 -= l.w * x11; } { const v4f l = GDN_L4(43, 3); x43 -= l.x * x12; x43 -= l.y * x13; x43 -= l.z * x14; x43 -= l.w * x15; } { const v4f l = GDN_L4(43, 4); x43 -= l.x * x16; x43 -= l.y * x17; x43 -= l.z * x18; x43 -= l.w * x19; } { const v4f l = GDN_L4(43, 5); x43 -= l.x * x20; x43 -= l.y * x21; x43 -= l.z * x22; x43 -= l.w * x23; } { const v4f l = GDN_L4(43, 6); x43 -= l.x * x24; x43 -= l.y * x25; x43 -= l.z * x26; x43 -= l.w * x27; } { const v4f l = GDN_L4(43, 7); x43 -= l.x * x28; x43 -= l.y * x29; x43 -= l.z * x30; x43 -= l.w * x31; } { const v4f l = GDN_L4(43, 8); x43 -= l.x * x32; x43 -= l.y * x33; x43 -= l.z * x34; x43 -= l.w * x35; } { const v4f l = GDN_L4(43, 9); x43 -= l.x * x36; x43 -= l.y * x37; x43 -= l.z * x38; x43 -= l.w * x39; } { const v4f l = GDN_L4(43, 10); x43 -= l.x * x40; x43 -= l.y * x41; x43 -= l.z * x42; } __builtin_amdgcn_sched_barrier(0);
        float x44 = GDN_RHS(44); { const v4f l = GDN_L4(44, 0); x44 -= l.x * x0; x44 -= l.y * x1; x44 -= l.z * x2; x44 -= l.w * x3; } { const v4f l = GDN_L4(44, 1); x44 -= l.x * x4; x44 -= l.y * x5; x44 -= l.z * x6; x44 -= l.w * x7; } { const v4f l = GDN_L4(44, 2); x44 -= l.x * x8; x44 -= l.y * x9; x44 -= l.z * x10; x44 -= l.w * x11; } { const v4f l = GDN_L4(44, 3); x44 -= l.x * x12; x44 -= l.y * x13; x44 -= l.z * x14; x44 -= l.w * x15; } { const v4f l = GDN_L4(44, 4); x44 -= l.x * x16; x44 -= l.y * x17; x44 -= l.z * x18; x44 -= l.w * x19; } { const v4f l = GDN_L4(44, 5); x44 -= l.x * x20; x44 -= l.y * x21; x44 -= l.z * x22; x44 -= l.w * x23; } { const v4f l = GDN_L4(44, 6); x44 -= l.x * x24; x44 -= l.y * x25; x44 -= l.z * x26; x44 -= l.w * x27; } { const v4f l = GDN_L4(44, 7); x44 -= l.x * x28; x44 -= l.y * x29; x44 -= l.z * x30; x44 -= l.w * x31; } { const v4f l = GDN_L4(44, 8); x44 -= l.x * x32; x44 -= l.y * x33; x44 -= l.z * x34; x44 -= l.w * x35; } { const v4f l = GDN_L4(44, 9); x44 -= l.x * x36; x44 -= l.y * x37; x44 -= l.z * x38; x44 -= l.w * x39; } { const v4f l = GDN_L4(44, 10); x44 -= l.x * x40; x44 -= l.y * x41; x44 -= l.z * x42; x44 -= l.w * x43; } __builtin_amdgcn_sched_barrier(0);
        float x45 = GDN_RHS(45); { const v4f l = GDN_L4(45, 0); x45 -= l.x * x0; x45 -= l.y * x1; x45 -= l.z * x2; x45 -= l.w * x3; } { const v4f l = GDN_L4(45, 1); x45 -= l.x * x4; x45 -= l.y * x5; x45 -= l.z * x6; x45 -= l.w * x7; } { const v4f l = GDN_L4(45, 2); x45 -= l.x * x8; x45 -= l.y * x9; x45 -= l.z * x10; x45 -= l.w * x11; } { const v4f l = GDN_L4(45, 3); x45 -= l.x * x12; x45 -= l.y * x13; x45 -= l.z * x14; x45 -= l.w * x15; } { const v4f l = GDN_L4(45, 4); x45 -= l.x * x16; x45 -= l.y * x17; x45 -= l.z * x18; x45 -= l.w * x19; } { const v4f l = GDN_L4(45, 5); x45 -= l.x * x20; x45 -= l.y * x21; x45 -= l.z * x22; x45 -= l.w * x23; } { const v4f l = GDN_L4(45, 6); x45 -= l.x * x24; x45 -= l.y * x25; x45 -= l.z * x26; x45 -= l.w * x27; } { const v4f l = GDN_L4(45, 7); x45 -= l.x * x28; x45 -= l.y * x29; x45 -= l.z * x30; x45 -= l.w * x31; } { const v4f l = GDN_L4(45, 8); x45 -= l.x * x32; x45 -= l.y * x33; x45 -= l.z * x34; x45 -= l.w * x35; } { const v4f l = GDN_L4(45, 9); x45 -= l.x * x36; x45 -= l.y * x37; x45 -= l.z * x38; x45 -= l.w * x39; } { const v4f l = GDN_L4(45, 10); x45 -= l.x * x40; x45 -= l.y * x41; x45 -= l.z * x42; x45 -= l.w * x43; } { const v4f l = GDN_L4(45, 11); x45 -= l.x * x44; } __builtin_amdgcn_sched_barrier(0);
        float x46 = GDN_RHS(46); { const v4f l = GDN_L4(46, 0); x46 -= l.x * x0; x46 -= l.y * x1; x46 -= l.z * x2; x46 -= l.w * x3; } { const v4f l = GDN_L4(46, 1); x46 -= l.x * x4; x46 -= l.y * x5; x46 -= l.z * x6; x46 -= l.w * x7; } { const v4f l = GDN_L4(46, 2); x46 -= l.x * x8; x46 -= l.y * x9; x46 -= l.z * x10; x46 -= l.w * x11; } { const v4f l = GDN_L4(46, 3); x46 -= l.x * x12; x46 -= l.y * x13; x46 -= l.z * x14; x46 -= l.w * x15; } { const v4f l = GDN_L4(46, 4); x46 -= l.x * x16; x46 -= l.y * x17; x46 -= l.z * x18; x46 -= l.w * x19; } { const v4f l = GDN_L4(46, 5); x46 -= l.x * x20; x46 -= l.y * x21; x46 -= l.z * x22; x46 -= l.w * x23; } { const v4f l = GDN_L4(46, 6); x46 -= l.x * x24; x46 -= l.y * x25; x46 -= l.z * x26; x46 -= l.w * x27; } { const v4f l = GDN_L4(46, 7); x46 -= l.x * x28; x46 -= l.y * x29; x46 -= l.z * x30; x46 -= l.w * x31; } { const v4f l = GDN_L4(46, 8); x46 -= l.x * x32; x46 -= l.y * x33; x46 -= l.z * x34; x46 -= l.w * x35; } { const v4f l = GDN_L4(46, 9); x46 -= l.x * x36; x46 -= l.y * x37; x46 -= l.z * x38; x46 -= l.w * x39; } { const v4f l = GDN_L4(46, 10); x46 -= l.x * x40; x46 -= l.y * x41; x46 -= l.z * x42; x46 -= l.w * x43; } { const v4f l = GDN_L4(46, 11); x46 -= l.x * x44; x46 -= l.y * x45; } __builtin_amdgcn_sched_barrier(0);
        float x47 = GDN_RHS(47); { const v4f l = GDN_L4(47, 0); x47 -= l.x * x0; x47 -= l.y * x1; x47 -= l.z * x2; x47 -= l.w * x3; } { const v4f l = GDN_L4(47, 1); x47 -= l.x * x4; x47 -= l.y * x5; x47 -= l.z * x6; x47 -= l.w * x7; } { const v4f l = GDN_L4(47, 2); x47 -= l.x * x8; x47 -= l.y * x9; x47 -= l.z * x10; x47 -= l.w * x11; } { const v4f l = GDN_L4(47, 3); x47 -= l.x * x12; x47 -= l.y * x13; x47 -= l.z * x14; x47 -= l.w * x15; } { const v4f l = GDN_L4(47, 4); x47 -= l.x * x16; x47 -= l.y * x17; x47 -= l.z * x18; x47 -= l.w * x19; } { const v4f l = GDN_L4(47, 5); x47 -= l.x * x20; x47 -= l.y * x21; x47 -= l.z * x22; x47 -= l.w * x23; } { const v4f l = GDN_L4(47, 6); x47 -= l.x * x24; x47 -= l.y * x25; x47 -= l.z * x26; x47 -= l.w * x27; } { const v4f l = GDN_L4(47, 7); x47 -= l.x * x28; x47 -= l.y * x29; x47 -= l.z * x30; x47 -= l.w * x31; } { const v4f l = GDN_L4(47, 8); x47 -= l.x * x32; x47 -= l.y * x33; x47 -= l.z * x34; x47 -= l.w * x35; } { const v4f l = GDN_L4(47, 9); x47 -= l.x * x36; x47 -= l.y * x37; x47 -= l.z * x38; x47 -= l.w * x39; } { const v4f l = GDN_L4(47, 10); x47 -= l.x * x40; x47 -= l.y * x41; x47 -= l.z * x42; x47 -= l.w * x43; } { const v4f l = GDN_L4(47, 11); x47 -= l.x * x44; x47 -= l.y * x45; x47 -= l.z * x46; } __builtin_amdgcn_sched_barrier(0);
        float x48 = GDN_RHS(48); { const v4f l = GDN_L4(48, 0); x48 -= l.x * x0; x48 -= l.y * x1; x48 -= l.z * x2; x48 -= l.w * x3; } { const v4f l = GDN_L4(48, 1); x48 -= l.x * x4; x48 -= l.y * x5; x48 -= l.z * x6; x48 -= l.w * x7; } { const v4f l = GDN_L4(48, 2); x48 -= l.x * x8; x48 -= l.y * x9; x48 -= l.z * x10; x48 -= l.w * x11; } { const v4f l = GDN_L4(48, 3); x48 -= l.x * x12; x48 -= l.y * x13; x48 -= l.z * x14; x48 -= l.w * x15; } { const v4f l = GDN_L4(48, 4); x48 -= l.x * x16; x48 -= l.y * x17; x48 -= l.z * x18; x48 -= l.w * x19; } { const v4f l = GDN_L4(48, 5); x48 -= l.x * x20; x48 -= l.y * x21; x48 -= l.z * x22; x48 -= l.w * x23; } { const v4f l = GDN_L4(48, 6); x48 -= l.x * x24; x48 -= l.y * x25; x48 -= l.z * x26; x48 -= l.w * x27; } { const v4f l = GDN_L4(48, 7); x48 -= l.x * x28; x48 -= l.y * x29; x48 -= l.z * x30; x48 -= l.w * x31; } { const v4f l = GDN_L4(48, 8); x48 -= l.x * x32; x48 -= l.y * x33; x48 -= l.z * x34; x48 -= l.w * x35; } { const v4f l = GDN_L4(48, 9); x48 -= l.x * x36; x48 -= l.y * x37; x48 -= l.z * x38; x48 -= l.w * x39; } { const v4f l = GDN_L4(48, 10); x48 -= l.x * x40; x48 -= l.y * x41; x48 -= l.z * x42; x48 -= l.w * x43; } { const v4f l = GDN_L4(48, 11); x48 -= l.x * x44; x48 -= l.y * x45; x48 -= l.z * x46; x48 -= l.w * x47; } __builtin_amdgcn_sched_barrier(0);
        float x49 = GDN_RHS(49); { const v4f l = GDN_L4(49, 0); x49 -= l.x * x0; x49 -= l.y * x1; x49 -= l.z * x2; x49 -= l.w * x3; } { const v4f l = GDN_L4(49, 1); x49 -= l.x * x4; x49 -= l.y * x5; x49 -= l.z * x6; x49 -= l.w * x7; } { const v4f l = GDN_L4(49, 2); x49 -= l.x * x8; x49 -= l.y * x9; x49 -= l.z * x10; x49 -= l.w * x11; } { const v4f l = GDN_L4(49, 3); x49 -= l.x * x12; x49 -= l.y * x13; x49 -= l.z * x14; x49 -= l.w * x15; } { const v4f l = GDN_L4(49, 4); x49 -= l.x * x16; x49 -= l.y * x17; x49 -= l.z * x18; x49 -= l.w * x19; } { const v4f l = GDN_L4(49, 5); x49 -= l.x * x20; x49 -= l.y * x21; x49 -= l.z * x22; x49 -= l.w * x23; } { const v4f l = GDN_L4(49, 6); x49 -= l.x * x24; x49 -= l.y * x25; x49 -= l.z * x26; x49 -= l.w * x27; } { const v4f l = GDN_L4(49, 7); x49 -= l.x * x28; x49 -= l.y * x29; x49 -= l.z * x30; x49 -= l.w * x31; } { const v4f l = GDN_L4(49, 8); x49 -= l.x * x32; x49 -= l.y * x33; x49 -= l.z * x34; x49 -= l.w * x35; } { const v4f l = GDN_L4(49, 9); x49 -= l.x * x36; x49 -= l.y * x37; x49 -= l.z * x38; x49 -= l.w * x39; } { const v4f l = GDN_L4(49, 10); x49 -= l.x * x40; x49 -= l.y * x41; x49 -= l.z * x42; x49 -= l.w * x43; } { const v4f l = GDN_L4(49, 11); x49 -= l.x * x44; x49 -= l.y * x45; x49 -= l.z * x46; x49 -= l.w * x47; } { const v4f l = GDN_L4(49, 12); x49 -= l.x * x48; } __builtin_amdgcn_sched_barrier(0);
        float x50 = GDN_RHS(50); { const v4f l = GDN_L4(50, 0); x50 -= l.x * x0; x50 -= l.y * x1; x50 -= l.z * x2; x50 -= l.w * x3; } { const v4f l = GDN_L4(50, 1); x50 -= l.x * x4; x50 -= l.y * x5; x50 -= l.z * x6; x50 -= l.w * x7; } { const v4f l = GDN_L4(50, 2); x50 -= l.x * x8; x50 -= l.y * x9; x50 -= l.z * x10; x50 -= l.w * x11; } { const v4f l = GDN_L4(50, 3); x50 -= l.x * x12; x50 -= l.y * x13; x50 -= l.z * x14; x50 -= l.w * x15; } { const v4f l = GDN_L4(50, 4); x50 -= l.x * x16; x50 -= l.y * x17; x50 -= l.z * x18; x50 -= l.w * x19; } { const v4f l = GDN_L4(50, 5); x50 -= l.x * x20; x50 -= l.y * x21; x50 -= l.z * x22; x50 -= l.w * x23; } { const v4f l = GDN_L4(50, 6); x50 -= l.x * x24; x50 -= l.y * x25; x50 -= l.z * x26; x50 -= l.w * x27; } { const v4f l = GDN_L4(50, 7); x50 -= l.x * x28; x50 -= l.y * x29; x50 -= l.z * x30; x50 -= l.w * x31; } { const v4f l = GDN_L4(50, 8); x50 -= l.x * x32; x50 -= l.y * x33; x50 -= l.z * x34; x50 -= l.w * x35; } { const v4f l = GDN_L4(50, 9); x50 -= l.x * x36; x50 -= l.y * x37; x50 -= l.z * x38; x50 -= l.w * x39; } { const v4f l = GDN_L4(50, 10); x50 -= l.x * x40; x50 -= l.y * x41; x50 -= l.z * x42; x50 -= l.w * x43; } { const v4f l = GDN_L4(50, 11); x50 -= l.x * x44; x50 -= l.y * x45; x50 -= l.z * x46; x50 -= l.w * x47; } { const v4f l = GDN_L4(50, 12); x50 -= l.x * x48; x50 -= l.y * x49; } __builtin_amdgcn_sched_barrier(0);
        float x51 = GDN_RHS(51); { const v4f l = GDN_L4(51, 0); x51 -= l.x * x0; x51 -= l.y * x1; x51 -= l.z * x2; x51 -= l.w * x3; } { const v4f l = GDN_L4(51, 1); x51 -= l.x * x4; x51 -= l.y * x5; x51 -= l.z * x6; x51 -= l.w * x7; } { const v4f l = GDN_L4(51, 2); x51 -= l.x * x8; x51 -= l.y * x9; x51 -= l.z * x10; x51 -= l.w * x11; } { const v4f l = GDN_L4(51, 3); x51 -= l.x * x12; x51 -= l.y * x13; x51 -= l.z * x14; x51 -= l.w * x15; } { const v4f l = GDN_L4(51, 4); x51 -= l.x * x16; x51 -= l.y * x17; x51 -= l.z * x18; x51 -= l.w * x19; } { const v4f l = GDN_L4(51, 5); x51 -= l.x * x20; x51 -= l.y * x21; x51 -= l.z * x22; x51 -= l.w * x23; } { const v4f l = GDN_L4(51, 6); x51 -= l.x * x24; x51 -= l.y * x25; x51 -= l.z * x26; x51 -= l.w * x27; } { const v4f l = GDN_L4(51, 7); x51 -= l.x * x28; x51 -= l.y * x29; x51 -= l.z * x30; x51 -= l.w * x31; } { const v4f l = GDN_L4(51, 8); x51 -= l.x * x32; x51 -= l.y * x33; x51 -= l.z * x34; x51 -= l.w * x35; } { const v4f l = GDN_L4(51, 9); x51 -= l.x * x36; x51 -= l.y * x37; x51 -= l.z * x38; x51 -= l.w * x39; } { const v4f l = GDN_L4(51, 10); x51 -= l.x * x40; x51 -= l.y * x41; x51 -= l.z * x42; x51 -= l.w * x43; } { const v4f l = GDN_L4(51, 11); x51 -= l.x * x44; x51 -= l.y * x45; x51 -= l.z * x46; x51 -= l.w * x47; } { const v4f l = GDN_L4(51, 12); x51 -= l.x * x48; x51 -= l.y * x49; x51 -= l.z * x50; } __builtin_amdgcn_sched_barrier(0);
        float x52 = GDN_RHS(52); { const v4f l = GDN_L4(52, 0); x52 -= l.x * x0; x52 -= l.y * x1; x52 -= l.z * x2; x52 -= l.w * x3; } { const v4f l = GDN_L4(52, 1); x52 -= l.x * x4; x52 -= l.y * x5; x52 -= l.z * x6; x52 -= l.w * x7; } { const v4f l = GDN_L4(52, 2); x52 -= l.x * x8; x52 -= l.y * x9; x52 -= l.z * x10; x52 -= l.w * x11; } { const v4f l = GDN_L4(52, 3); x52 -= l.x * x12; x52 -= l.y * x13; x52 -= l.z * x14; x52 -= l.w * x15; } { const v4f l = GDN_L4(52, 4); x52 -= l.x * x16; x52 -= l.y * x17; x52 -= l.z * x18; x52 -= l.w * x19; } { const v4f l = GDN_L4(52, 5); x52 -= l.x * x20; x52 -= l.y * x21; x52 -= l.z * x22; x52 -= l.w * x23; } { const v4f l = GDN_L4(52, 6); x52 -= l.x * x24; x52 -= l.y * x25; x52 -= l.z * x26; x52 -= l.w * x27; } { const v4f l = GDN_L4(52, 7); x52 -= l.x * x28; x52 -= l.y * x29; x52 -= l.z * x30; x52 -= l.w * x31; } { const v4f l = GDN_L4(52, 8); x52 -= l.x * x32; x52 -= l.y * x33; x52 -= l.z * x34; x52 -= l.w * x35; } { const v4f l = GDN_L4(52, 9); x52 -= l.x * x36; x52 -= l.y * x37; x52 -= l.z * x38; x52 -= l.w * x39; } { const v4f l = GDN_L4(52, 10); x52 -= l.x * x40; x52 -= l.y * x41; x52 -= l.z * x42; x52 -= l.w * x43; } { const v4f l = GDN_L4(52, 11); x52 -= l.x * x44; x52 -= l.y * x45; x52 -= l.z * x46; x52 -= l.w * x47; } { const v4f l = GDN_L4(52, 12); x52 -= l.x * x48; x52 -= l.y * x49; x52 -= l.z * x50; x52 -= l.w * x51; } __builtin_amdgcn_sched_barrier(0);
        float x53 = GDN_RHS(53); { const v4f l = GDN_L4(53, 0); x53 -= l.x * x0; x53 -= l.y * x1; x53 -= l.z * x2; x53 -= l.w * x3; } { const v4f l = GDN_L4(53, 1); x53 -= l.x * x4; x53 -= l.y * x5; x53 -= l.z * x6; x53 -= l.w * x7; } { const v4f l = GDN_L4(53, 2); x53 -= l.x * x8; x53 -= l.y * x9; x53 -= l.z * x10; x53 -= l.w * x11; } { const v4f l = GDN_L4(53, 3); x53 -= l.x * x12; x53 -= l.y * x13; x53 -= l.z * x14; x53 -= l.w * x15; } { const v4f l = GDN_L4(53, 4); x53 -= l.x * x16; x53 -= l.y * x17; x53 -= l.z * x18; x53 -= l.w * x19; } { const v4f l = GDN_L4(53, 5); x53 -= l.x * x20; x53 -= l.y * x21; x53 -= l.z * x22; x53 -= l.w * x23; } { const v4f l = GDN_L4(53, 6); x53 -= l.x * x24; x53 -= l.y * x25; x53 -= l.z * x26; x53 -= l.w * x27; } { const v4f l = GDN_L4(53, 7); x53 -= l.x * x28; x53 -= l.y * x29; x53 -= l.z * x30; x53 -= l.w * x31; } { const v4f l = GDN_L4(53, 8); x53 -= l.x * x32; x53 -= l.y * x33; x53 -= l.z * x34; x53 -= l.w * x35; } { const v4f l = GDN_L4(53, 9); x53 -= l.x * x36; x53 -= l.y * x37; x53 -= l.z * x38; x53 -= l.w * x39; } { const v4f l = GDN_L4(53, 10); x53 -= l.x * x40; x53 -= l.y * x41; x53 -= l.z * x42; x53 -= l.w * x43; } { const v4f l = GDN_L4(53, 11); x53 -= l.x * x44; x53 -= l.y * x45; x53 -= l.z * x46; x53 -= l.w * x47; } { const v4f l = GDN_L4(53, 12); x53 -= l.x * x48; x53 -= l.y * x49; x53 -= l.z * x50; x53 -= l.w * x51; } { const v4f l = GDN_L4(53, 13); x53 -= l.x * x52; } __builtin_amdgcn_sched_barrier(0);
        float x54 = GDN_RHS(54); { const v4f l = GDN_L4(54, 0); x54 -= l.x * x0; x54 -= l.y * x1; x54 -= l.z * x2; x54 -= l.w * x3; } { const v4f l = GDN_L4(54, 1); x54 -= l.x * x4; x54 -= l.y * x5; x54 -= l.z * x6; x54 -= l.w * x7; } { const v4f l = GDN_L4(54, 2); x54 -= l.x * x8; x54 -= l.y * x9; x54 -= l.z * x10; x54 -= l.w * x11; } { const v4f l = GDN_L4(54, 3); x54 -= l.x * x12; x54 -= l.y * x13; x54 -= l.z * x14; x54 -= l.w * x15; } { const v4f l = GDN_L4(54, 4); x54 -= l.x * x16; x54 -= l.y * x17; x54 -= l.z * x18; x54 -= l.w * x19; } { const v4f l = GDN_L4(54, 5); x54 -= l.x * x20; x54 -= l.y * x21; x54 -= l.z * x22; x54 -= l.w * x23; } { const v4f l = GDN_L4(54, 6); x54 -= l.x * x24; x54 -= l.y * x25; x54 -= l.z * x26; x54 -= l.w * x27; } { const v4f l = GDN_L4(54, 7); x54 -= l.x * x28; x54 -= l.y * x29; x54 -= l.z * x30; x54 -= l.w * x31; } { const v4f l = GDN_L4(54, 8); x54 -= l.x * x32; x54 -= l.y * x33; x54 -= l.z * x34; x54 -= l.w * x35; } { const v4f l = GDN_L4(54, 9); x54 -= l.x * x36; x54 -= l.y * x37; x54 -= l.z * x38; x54 -= l.w * x39; } { const v4f l = GDN_L4(54, 10); x54 -= l.x * x40; x54 -= l.y * x41; x54 -= l.z * x42; x54 -= l.w * x43; } { const v4f l = GDN_L4(54, 11); x54 -= l.x * x44; x54 -= l.y * x45; x54 -= l.z * x46; x54 -= l.w * x47; } { const v4f l = GDN_L4(54, 12); x54 -= l.x * x48; x54 -= l.y * x49; x54 -= l.z * x50; x54 -= l.w * x51; } { const v4f l = GDN_L4(54, 13); x54 -= l.x * x52; x54 -= l.y * x53; } __builtin_amdgcn_sched_barrier(0);
        float x55 = GDN_RHS(55); { const v4f l = GDN_L4(55, 0); x55 -= l.x * x0; x55 -= l.y * x1; x55 -= l.z * x2; x55 -= l.w * x3; } { const v4f l = GDN_L4(55, 1); x55 -= l.x * x4; x55 -= l.y * x5; x55 -= l.z * x6; x55 -= l.w * x7; } { const v4f l = GDN_L4(55, 2); x55 -= l.x * x8; x55 -= l.y * x9; x55 -= l.z * x10; x55 -= l.w * x11; } { const v4f l = GDN_L4(55, 3); x55 -= l.x * x12; x55 -= l.y * x13; x55 -= l.z * x14; x55 -= l.w * x15; } { const v4f l = GDN_L4(55, 4); x55 -= l.x * x16; x55 -= l.y * x17; x55 -= l.z * x18; x55 -= l.w * x19; } { const v4f l = GDN_L4(55, 5); x55 -= l.x * x20; x55 -= l.y * x21; x55 -= l.z * x22; x55 -= l.w * x23; } { const v4f l = GDN_L4(55, 6); x55 -= l.x * x24; x55 -= l.y * x25; x55 -= l.z * x26; x55 -= l.w * x27; } { const v4f l = GDN_L4(55, 7); x55 -= l.x * x28; x55 -= l.y * x29; x55 -= l.z * x30; x55 -= l.w * x31; } { const v4f l = GDN_L4(55, 8); x55 -= l.x * x32; x55 -= l.y * x33; x55 -= l.z * x34; x55 -= l.w * x35; } { const v4f l = GDN_L4(55, 9); x55 -= l.x * x36; x55 -= l.y * x37; x55 -= l.z * x38; x55 -= l.w * x39; } { const v4f l = GDN_L4(55, 10); x55 -= l.x * x40; x55 -= l.y * x41; x55 -= l.z * x42; x55 -= l.w * x43; } { const v4f l = GDN_L4(55, 11); x55 -= l.x * x44; x55 -= l.y * x45; x55 -= l.z * x46; x55 -= l.w * x47; } { const v4f l = GDN_L4(55, 12); x55 -= l.x * x48; x55 -= l.y * x49; x55 -= l.z * x50; x55 -= l.w * x51; } { const v4f l = GDN_L4(55, 13); x55 -= l.x * x52; x55 -= l.y * x53; x55 -= l.z * x54; } __builtin_amdgcn_sched_barrier(0);
        float x56 = GDN_RHS(56); { const v4f l = GDN_L4(56, 0); x56 -= l.x * x0; x56 -= l.y * x1; x56 -= l.z * x2; x56 -= l.w * x3; } { const v4f l = GDN_L4(56, 1); x56 -= l.x * x4; x56 -= l.y * x5; x56 -= l.z * x6; x56 -= l.w * x7; } { const v4f l = GDN_L4(56, 2); x56 -= l.x * x8; x56 -= l.y * x9; x56 -= l.z * x10; x56 -= l.w * x11; } { const v4f l = GDN_L4(56, 3); x56 -= l.x * x12; x56 -= l.y * x13; x56 -= l.z * x14; x56 -= l.w * x15; } { const v4f l = GDN_L4(56, 4); x56 -= l.x * x16; x56 -= l.y * x17; x56 -= l.z * x18; x56 -= l.w * x19; } { const v4f l = GDN_L4(56, 5); x56 -= l.x * x20; x56 -= l.y * x21; x56 -= l.z * x22; x56 -= l.w * x23; } { const v4f l = GDN_L4(56, 6); x56 -= l.x * x24; x56 -= l.y * x25; x56 -= l.z * x26; x56 -= l.w * x27; } { const v4f l = GDN_L4(56, 7); x56 -= l.x * x28; x56 -= l.y * x29; x56 -= l.z * x30; x56 -= l.w * x31; } { const v4f l = GDN_L4(56, 8); x56 -= l.x * x32; x56 -= l.y * x33; x56 -= l.z * x34; x56 -= l.w * x35; } { const v4f l = GDN_L4(56, 9); x56 -= l.x * x36; x56 -= l.y * x37; x56 -= l.z * x38; x56 -= l.w * x39; } { const v4f l = GDN_L4(56, 10); x56 -= l.x * x40; x56 -= l.y * x41; x56 -= l.z * x42; x56 -= l.w * x43; } { const v4f l = GDN_L4(56, 11); x56 -= l.x * x44; x56 -= l.y * x45; x56 -= l.z * x46; x56 -= l.w * x47; } { const v4f l = GDN_L4(56, 12); x56 -= l.x * x48; x56 -= l.y * x49; x56 -= l.z * x50; x56 -= l.w * x51; } { const v4f l = GDN_L4(56, 13); x56 -= l.x * x52; x56 -= l.y * x53; x56 -= l.z * x54; x56 -= l.w * x55; } __builtin_amdgcn_sched_barrier(0);
        float x57 = GDN_RHS(57); { const v4f l = GDN_L4(57, 0); x57 -= l.x * x0; x57 -= l.y * x1; x57 -= l.z * x2; x57 -= l.w * x3; } { const v4f l = GDN_L4(57, 1); x57 -= l.x * x4; x57 -= l.y * x5; x57 -= l.z * x6; x57 -= l.w * x7; } { const v4f l = GDN_L4(57, 2); x57 -= l.x * x8; x57 -= l.y * x9; x57 -= l.z * x10; x57 -= l.w * x11; } { const v4f l = GDN_L4(57, 3); x57 -= l.x * x12; x57 -= l.y * x13; x57 -= l.z * x14; x57 -= l.w * x15; } { const v4f l = GDN_L4(57, 4); x57 -= l.x * x16; x57 -= l.y * x17; x57 -= l.z * x18; x57 -= l.w * x19; } { const v4f l = GDN_L4(57, 5); x57 -= l.x * x20; x57 -= l.y * x21; x57 -= l.z * x22; x57 -= l.w * x23; } { const v4f l = GDN_L4(57, 6); x57 -= l.x * x24; x57 -= l.y * x25; x57 -= l.z * x26; x57 -= l.w * x27; } { const v4f l = GDN_L4(57, 7); x57 -= l.x * x28; x57 -= l.y * x29; x57 -= l.z * x30; x57 -= l.w * x31; } { const v4f l = GDN_L4(57, 8); x57 -= l.x * x32; x57 -= l.y * x33; x57 -= l.z * x34; x57 -= l.w * x35; } { const v4f l = GDN_L4(57, 9); x57 -= l.x * x36; x57 -= l.y * x37; x57 -= l.z * x38; x57 -= l.w * x39; } { const v4f l = GDN_L4(57, 10); x57 -= l.x * x40; x57 -= l.y * x41; x57 -= l.z * x42; x57 -= l.w * x43; } { const v4f l = GDN_L4(57, 11); x57 -= l.x * x44; x57 -= l.y * x45; x57 -= l.z * x46; x57 -= l.w * x47; } { const v4f l = GDN_L4(57, 12); x57 -= l.x * x48; x57 -= l.y * x49; x57 -= l.z * x50; x57 -= l.w * x51; } { const v4f l = GDN_L4(57, 13); x57 -= l.x * x52; x57 -= l.y * x53; x57 -= l.z * x54; x57 -= l.w * x55; } { const v4f l = GDN_L4(57, 14); x57 -= l.x * x56; } __builtin_amdgcn_sched_barrier(0);
        float x58 = GDN_RHS(58); { const v4f l = GDN_L4(58, 0); x58 -= l.x * x0; x58 -= l.y * x1; x58 -= l.z * x2; x58 -= l.w * x3; } { const v4f l = GDN_L4(58, 1); x58 -= l.x * x4; x58 -= l.y * x5; x58 -= l.z * x6; x58 -= l.w * x7; } { const v4f l = GDN_L4(58, 2); x58 -= l.x * x8; x58 -= l.y * x9; x58 -= l.z * x10; x58 -= l.w * x11; } { const v4f l = GDN_L4(58, 3); x58 -= l.x * x12; x58 -= l.y * x13; x58 -= l.z * x14; x58 -= l.w * x15; } { const v4f l = GDN_L4(58, 4); x58 -= l.x * x16; x58 -= l.y * x17; x58 -= l.z * x18; x58 -= l.w * x19; } { const v4f l = GDN_L4(58, 5); x58 -= l.x * x20; x58 -= l.y * x21; x58 -= l.z * x22; x58 -= l.w * x23; } { const v4f l = GDN_L4(58, 6); x58 -= l.x * x24; x58 -= l.y * x25; x58 -= l.z * x26; x58 -= l.w * x27; } { const v4f l = GDN_L4(58, 7); x58 -= l.x * x28; x58 -= l.y * x29; x58 -= l.z * x30; x58 -= l.w * x31; } { const v4f l = GDN_L4(58, 8); x58 -= l.x * x32; x58 -= l.y * x33; x58 -= l.z * x34; x58 -= l.w * x35; } { const v4f l = GDN_L4(58, 9); x58 -= l.x * x36; x58 -= l.y * x37; x58 -= l.z * x38; x58 -= l.w * x39; } { const v4f l = GDN_L4(58, 10); x58 -= l.x * x40; x58 -= l.y * x41; x58 -= l.z * x42; x58 -= l.w * x43; } { const v4f l = GDN_L4(58, 11); x58 -= l.x * x44; x58 -= l.y * x45; x58 -= l.z * x46; x58 -= l.w * x47; } { const v4f l = GDN_L4(58, 12); x58 -= l.x * x48; x58 -= l.y * x49; x58 -= l.z * x50; x58 -= l.w * x51; } { const v4f l = GDN_L4(58, 13); x58 -= l.x * x52; x58 -= l.y * x53; x58 -= l.z * x54; x58 -= l.w * x55; } { const v4f l = GDN_L4(58, 14); x58 -= l.x * x56; x58 -= l.y * x57; } __builtin_amdgcn_sched_barrier(0);
        float x59 = GDN_RHS(59); { const v4f l = GDN_L4(59, 0); x59 -= l.x * x0; x59 -= l.y * x1; x59 -= l.z * x2; x59 -= l.w * x3; } { const v4f l = GDN_L4(59, 1); x59 -= l.x * x4; x59 -= l.y * x5; x59 -= l.z * x6; x59 -= l.w * x7; } { const v4f l = GDN_L4(59, 2); x59 -= l.x * x8; x59 -= l.y * x9; x59 -= l.z * x10; x59 -= l.w * x11; } { const v4f l = GDN_L4(59, 3); x59 -= l.x * x12; x59 -= l.y * x13; x59 -= l.z * x14; x59 -= l.w * x15; } { const v4f l = GDN_L4(59, 4); x59 -= l.x * x16; x59 -= l.y * x17; x59 -= l.z * x18; x59 -= l.w * x19; } { const v4f l = GDN_L4(59, 5); x59 -= l.x * x20; x59 -= l.y * x21; x59 -= l.z * x22; x59 -= l.w * x23; } { const v4f l = GDN_L4(59, 6); x59 -= l.x * x24; x59 -= l.y * x25; x59 -= l.z * x26; x59 -= l.w * x27; } { const v4f l = GDN_L4(59, 7); x59 -= l.x * x28; x59 -= l.y * x29; x59 -= l.z * x30; x59 -= l.w * x31; } { const v4f l = GDN_L4(59, 8); x59 -= l.x * x32; x59 -= l.y * x33; x59 -= l.z * x34; x59 -= l.w * x35; } { const v4f l = GDN_L4(59, 9); x59 -= l.x * x36; x59 -= l.y * x37; x59 -= l.z * x38; x59 -= l.w * x39; } { const v4f l = GDN_L4(59, 10); x59 -= l.x * x40; x59 -= l.y * x41; x59 -= l.z * x42; x59 -= l.w * x43; } { const v4f l = GDN_L4(59, 11); x59 -= l.x * x44; x59 -= l.y * x45; x59 -= l.z * x46; x59 -= l.w * x47; } { const v4f l = GDN_L4(59, 12); x59 -= l.x * x48; x59 -= l.y * x49; x59 -= l.z * x50; x59 -= l.w * x51; } { const v4f l = GDN_L4(59, 13); x59 -= l.x * x52; x59 -= l.y * x53; x59 -= l.z * x54; x59 -= l.w * x55; } { const v4f l = GDN_L4(59, 14); x59 -= l.x * x56; x59 -= l.y * x57; x59 -= l.z * x58; } __builtin_amdgcn_sched_barrier(0);
        float x60 = GDN_RHS(60); { const v4f l = GDN_L4(60, 0); x60 -= l.x * x0; x60 -= l.y * x1; x60 -= l.z * x2; x60 -= l.w * x3; } { const v4f l = GDN_L4(60, 1); x60 -= l.x * x4; x60 -= l.y * x5; x60 -= l.z * x6; x60 -= l.w * x7; } { const v4f l = GDN_L4(60, 2); x60 -= l.x * x8; x60 -= l.y * x9; x60 -= l.z * x10; x60 -= l.w * x11; } { const v4f l = GDN_L4(60, 3); x60 -= l.x * x12; x60 -= l.y * x13; x60 -= l.z * x14; x60 -= l.w * x15; } { const v4f l = GDN_L4(60, 4); x60 -= l.x * x16; x60 -= l.y * x17; x60 -= l.z * x18; x60 -= l.w * x19; } { const v4f l = GDN_L4(60, 5); x60 -= l.x * x20; x60 -= l.y * x21; x60 -= l.z * x22; x60 -= l.w * x23; } { const v4f l = GDN_L4(60, 6); x60 -= l.x * x24; x60 -= l.y * x25; x60 -= l.z * x26; x60 -= l.w * x27; } { const v4f l = GDN_L4(60, 7); x60 -= l.x * x28; x60 -= l.y * x29; x60 -= l.z * x30; x60 -= l.w * x31; } { const v4f l = GDN_L4(60, 8); x60 -= l.x * x32; x60 -= l.y * x33; x60 -= l.z * x34; x60 -= l.w * x35; } { const v4f l = GDN_L4(60, 9); x60 -= l.x * x36; x60 -= l.y * x37; x60 -= l.z * x38; x60 -= l.w * x39; } { const v4f l = GDN_L4(60, 10); x60 -= l.x * x40; x60 -= l.y * x41; x60 -= l.z * x42; x60 -= l.w * x43; } { const v4f l = GDN_L4(60, 11); x60 -= l.x * x44; x60 -= l.y * x45; x60 -= l.z * x46; x60 -= l.w * x47; } { const v4f l = GDN_L4(60, 12); x60 -= l.x * x48; x60 -= l.y * x49; x60 -= l.z * x50; x60 -= l.w * x51; } { const v4f l = GDN_L4(60, 13); x60 -= l.x * x52; x60 -= l.y * x53; x60 -= l.z * x54; x60 -= l.w * x55; } { const v4f l = GDN_L4(60, 14); x60 -= l.x * x56; x60 -= l.y * x57; x60 -= l.z * x58; x60 -= l.w * x59; } __builtin_amdgcn_sched_barrier(0);
        float x61 = GDN_RHS(61); { const v4f l = GDN_L4(61, 0); x61 -= l.x * x0; x61 -= l.y * x1; x61 -= l.z * x2; x61 -= l.w * x3; } { const v4f l = GDN_L4(61, 1); x61 -= l.x * x4; x61 -= l.y * x5; x61 -= l.z * x6; x61 -= l.w * x7; } { const v4f l = GDN_L4(61, 2); x61 -= l.x * x8; x61 -= l.y * x9; x61 -= l.z * x10; x61 -= l.w * x11; } { const v4f l = GDN_L4(61, 3); x61 -= l.x * x12; x61 -= l.y * x13; x61 -= l.z * x14; x61 -= l.w * x15; } { const v4f l = GDN_L4(61, 4); x61 -= l.x * x16; x61 -= l.y * x17; x61 -= l.z * x18; x61 -= l.w * x19; } { const v4f l = GDN_L4(61, 5); x61 -= l.x * x20; x61 -= l.y * x21; x61 -= l.z * x22; x61 -= l.w * x23; } { const v4f l = GDN_L4(61, 6); x61 -= l.x * x24; x61 -= l.y * x25; x61 -= l.z * x26; x61 -= l.w * x27; } { const v4f l = GDN_L4(61, 7); x61 -= l.x * x28; x61 -= l.y * x29; x61 -= l.z * x30; x61 -= l.w * x31; } { const v4f l = GDN_L4(61, 8); x61 -= l.x * x32; x61 -= l.y * x33; x61 -= l.z * x34; x61 -= l.w * x35; } { const v4f l = GDN_L4(61, 9); x61 -= l.x * x36; x61 -= l.y * x37; x61 -= l.z * x38; x61 -= l.w * x39; } { const v4f l = GDN_L4(61, 10); x61 -= l.x * x40; x61 -= l.y * x41; x61 -= l.z * x42; x61 -= l.w * x43; } { const v4f l = GDN_L4(61, 11); x61 -= l.x * x44; x61 -= l.y * x45; x61 -= l.z * x46; x61 -= l.w * x47; } { const v4f l = GDN_L4(61, 12); x61 -= l.x * x48; x61 -= l.y * x49; x61 -= l.z * x50; x61 -= l.w * x51; } { const v4f l = GDN_L4(61, 13); x61 -= l.x * x52; x61 -= l.y * x53; x61 -= l.z * x54; x61 -= l.w * x55; } { const v4f l = GDN_L4(61, 14); x61 -= l.x * x56; x61 -= l.y * x57; x61 -= l.z * x58; x61 -= l.w * x59; } { const v4f l = GDN_L4(61, 15); x61 -= l.x * x60; } __builtin_amdgcn_sched_barrier(0);
        float x62 = GDN_RHS(62); { const v4f l = GDN_L4(62, 0); x62 -= l.x * x0; x62 -= l.y * x1; x62 -= l.z * x2; x62 -= l.w * x3; } { const v4f l = GDN_L4(62, 1); x62 -= l.x * x4; x62 -= l.y * x5; x62 -= l.z * x6; x62 -= l.w * x7; } { const v4f l = GDN_L4(62, 2); x62 -= l.x * x8; x62 -= l.y * x9; x62 -= l.z * x10; x62 -= l.w * x11; } { const v4f l = GDN_L4(62, 3); x62 -= l.x * x12; x62 -= l.y * x13; x62 -= l.z * x14; x62 -= l.w * x15; } { const v4f l = GDN_L4(62, 4); x62 -= l.x * x16; x62 -= l.y * x17; x62 -= l.z * x18; x62 -= l.w * x19; } { const v4f l = GDN_L4(62, 5); x62 -= l.x * x20; x62 -= l.y * x21; x62 -= l.z * x22; x62 -= l.w * x23; } { const v4f l = GDN_L4(62, 6); x62 -= l.x * x24; x62 -= l.y * x25; x62 -= l.z * x26; x62 -= l.w * x27; } { const v4f l = GDN_L4(62, 7); x62 -= l.x * x28; x62 -= l.y * x29; x62 -= l.z * x30; x62 -= l.w * x31; } { const v4f l = GDN_L4(62, 8); x62 -= l.x * x32; x62 -= l.y * x33; x62 -= l.z * x34; x62 -= l.w * x35; } { const v4f l = GDN_L4(62, 9); x62 -= l.x * x36; x62 -= l.y * x37; x62 -= l.z * x38; x62 -= l.w * x39; } { const v4f l = GDN_L4(62, 10); x62 -= l.x * x40; x62 -= l.y * x41; x62 -= l.z * x42; x62 -= l.w * x43; } { const v4f l = GDN_L4(62, 11); x62 -= l.x * x44; x62 -= l.y * x45; x62 -= l.z * x46; x62 -= l.w * x47; } { const v4f l = GDN_L4(62, 12); x62 -= l.x * x48; x62 -= l.y * x49; x62 -= l.z * x50; x62 -= l.w * x51; } { const v4f l = GDN_L4(62, 13); x62 -= l.x * x52; x62 -= l.y * x53; x62 -= l.z * x54; x62 -= l.w * x55; } { const v4f l = GDN_L4(62, 14); x62 -= l.x * x56; x62 -= l.y * x57; x62 -= l.z * x58; x62 -= l.w * x59; } { const v4f l = GDN_L4(62, 15); x62 -= l.x * x60; x62 -= l.y * x61; } __builtin_amdgcn_sched_barrier(0);
        float x63 = GDN_RHS(63); { const v4f l = GDN_L4(63, 0); x63 -= l.x * x0; x63 -= l.y * x1; x63 -= l.z * x2; x63 -= l.w * x3; } { const v4f l = GDN_L4(63, 1); x63 -= l.x * x4; x63 -= l.y * x5; x63 -= l.z * x6; x63 -= l.w * x7; } { const v4f l = GDN_L4(63, 2); x63 -= l.x * x8; x63 -= l.y * x9; x63 -= l.z * x10; x63 -= l.w * x11; } { const v4f l = GDN_L4(63, 3); x63 -= l.x * x12; x63 -= l.y * x13; x63 -= l.z * x14; x63 -= l.w * x15; } { const v4f l = GDN_L4(63, 4); x63 -= l.x * x16; x63 -= l.y * x17; x63 -= l.z * x18; x63 -= l.w * x19; } { const v4f l = GDN_L4(63, 5); x63 -= l.x * x20; x63 -= l.y * x21; x63 -= l.z * x22; x63 -= l.w * x23; } { const v4f l = GDN_L4(63, 6); x63 -= l.x * x24; x63 -= l.y * x25; x63 -= l.z * x26; x63 -= l.w * x27; } { const v4f l = GDN_L4(63, 7); x63 -= l.x * x28; x63 -= l.y * x29; x63 -= l.z * x30; x63 -= l.w * x31; } { const v4f l = GDN_L4(63, 8); x63 -= l.x * x32; x63 -= l.y * x33; x63 -= l.z * x34; x63 -= l.w * x35; } { const v4f l = GDN_L4(63, 9); x63 -= l.x * x36; x63 -= l.y * x37; x63 -= l.z * x38; x63 -= l.w * x39; } { const v4f l = GDN_L4(63, 10); x63 -= l.x * x40; x63 -= l.y * x41; x63 -= l.z * x42; x63 -= l.w * x43; } { const v4f l = GDN_L4(63, 11); x63 -= l.x * x44; x63 -= l.y * x45; x63 -= l.z * x46; x63 -= l.w * x47; } { const v4f l = GDN_L4(63, 12); x63 -= l.x * x48; x63 -= l.y * x49; x63 -= l.z * x50; x63 -= l.w * x51; } { const v4f l = GDN_L4(63, 13); x63 -= l.x * x52; x63 -= l.y * x53; x63 -= l.z * x54; x63 -= l.w * x55; } { const v4f l = GDN_L4(63, 14); x63 -= l.x * x56; x63 -= l.y * x57; x63 -= l.z * x58; x63 -= l.w * x59; } { const v4f l = GDN_L4(63, 15); x63 -= l.x * x60; x63 -= l.y * x61; x63 -= l.z * x62; } __builtin_amdgcn_sched_barrier(0);
        if (c < 128) { GU[0 * 128 + c] = x0; GU[1 * 128 + c] = x1; GU[2 * 128 + c] = x2; GU[3 * 128 + c] = x3; GU[4 * 128 + c] = x4; GU[5 * 128 + c] = x5; GU[6 * 128 + c] = x6; GU[7 * 128 + c] = x7; GU[8 * 128 + c] = x8; GU[9 * 128 + c] = x9; GU[10 * 128 + c] = x10; GU[11 * 128 + c] = x11; GU[12 * 128 + c] = x12; GU[13 * 128 + c] = x13; GU[14 * 128 + c] = x14; GU[15 * 128 + c] = x15; GU[16 * 128 + c] = x16; GU[17 * 128 + c] = x17; GU[18 * 128 + c] = x18; GU[19 * 128 + c] = x19; GU[20 * 128 + c] = x20; GU[21 * 128 + c] = x21; GU[22 * 128 + c] = x22; GU[23 * 128 + c] = x23; GU[24 * 128 + c] = x24; GU[25 * 128 + c] = x25; GU[26 * 128 + c] = x26; GU[27 * 128 + c] = x27; GU[28 * 128 + c] = x28; GU[29 * 128 + c] = x29; GU[30 * 128 + c] = x30; GU[31 * 128 + c] = x31; GU[32 * 128 + c] = x32; GU[33 * 128 + c] = x33; GU[34 * 128 + c] = x34; GU[35 * 128 + c] = x35; GU[36 * 128 + c] = x36; GU[37 * 128 + c] = x37; GU[38 * 128 + c] = x38; GU[39 * 128 + c] = x39; GU[40 * 128 + c] = x40; GU[41 * 128 + c] = x41; GU[42 * 128 + c] = x42; GU[43 * 128 + c] = x43; GU[44 * 128 + c] = x44; GU[45 * 128 + c] = x45; GU[46 * 128 + c] = x46; GU[47 * 128 + c] = x47; GU[48 * 128 + c] = x48; GU[49 * 128 + c] = x49; GU[50 * 128 + c] = x50; GU[51 * 128 + c] = x51; GU[52 * 128 + c] = x52; GU[53 * 128 + c] = x53; GU[54 * 128 + c] = x54; GU[55 * 128 + c] = x55; GU[56 * 128 + c] = x56; GU[57 * 128 + c] = x57; GU[58 * 128 + c] = x58; GU[59 * 128 + c] = x59; GU[60 * 128 + c] = x60; GU[61 * 128 + c] = x61; GU[62 * 128 + c] = x62; GU[63 * 128 + c] = x63; }
        else { GNW[0 * 128 + (c - 128)] = (bf16)f2bf(-x0); GNW[1 * 128 + (c - 128)] = (bf16)f2bf(-x1); GNW[2 * 128 + (c - 128)] = (bf16)f2bf(-x2); GNW[3 * 128 + (c - 128)] = (bf16)f2bf(-x3); GNW[4 * 128 + (c - 128)] = (bf16)f2bf(-x4); GNW[5 * 128 + (c - 128)] = (bf16)f2bf(-x5); GNW[6 * 128 + (c - 128)] = (bf16)f2bf(-x6); GNW[7 * 128 + (c - 128)] = (bf16)f2bf(-x7); GNW[8 * 128 + (c - 128)] = (bf16)f2bf(-x8); GNW[9 * 128 + (c - 128)] = (bf16)f2bf(-x9); GNW[10 * 128 + (c - 128)] = (bf16)f2bf(-x10); GNW[11 * 128 + (c - 128)] = (bf16)f2bf(-x11); GNW[12 * 128 + (c - 128)] = (bf16)f2bf(-x12); GNW[13 * 128 + (c - 128)] = (bf16)f2bf(-x13); GNW[14 * 128 + (c - 128)] = (bf16)f2bf(-x14); GNW[15 * 128 + (c - 128)] = (bf16)f2bf(-x15); GNW[16 * 128 + (c - 128)] = (bf16)f2bf(-x16); GNW[17 * 128 + (c - 128)] = (bf16)f2bf(-x17); GNW[18 * 128 + (c - 128)] = (bf16)f2bf(-x18); GNW[19 * 128 + (c - 128)] = (bf16)f2bf(-x19); GNW[20 * 128 + (c - 128)] = (bf16)f2bf(-x20); GNW[21 * 128 + (c - 128)] = (bf16)f2bf(-x21); GNW[22 * 128 + (c - 128)] = (bf16)f2bf(-x22); GNW[23 * 128 + (c - 128)] = (bf16)f2bf(-x23); GNW[24 * 128 + (c - 128)] = (bf16)f2bf(-x24); GNW[25 * 128 + (c - 128)] = (bf16)f2bf(-x25); GNW[26 * 128 + (c - 128)] = (bf16)f2bf(-x26); GNW[27 * 128 + (c - 128)] = (bf16)f2bf(-x27); GNW[28 * 128 + (c - 128)] = (bf16)f2bf(-x28); GNW[29 * 128 + (c - 128)] = (bf16)f2bf(-x29); GNW[30 * 128 + (c - 128)] = (bf16)f2bf(-x30); GNW[31 * 128 + (c - 128)] = (bf16)f2bf(-x31); GNW[32 * 128 + (c - 128)] = (bf16)f2bf(-x32); GNW[33 * 128 + (c - 128)] = (bf16)f2bf(-x33); GNW[34 * 128 + (c - 128)] = (bf16)f2bf(-x34); GNW[35 * 128 + (c - 128)] = (bf16)f2bf(-x35); GNW[36 * 128 + (c - 128)] = (bf16)f2bf(-x36); GNW[37 * 128 + (c - 128)] = (bf16)f2bf(-x37); GNW[38 * 128 + (c - 128)] = (bf16)f2bf(-x38); GNW[39 * 128 + (c - 128)] = (bf16)f2bf(-x39); GNW[40 * 128 + (c - 128)] = (bf16)f2bf(-x40); GNW[41 * 128 + (c - 128)] = (bf16)f2bf(-x41); GNW[42 * 128 + (c - 128)] = (bf16)f2bf(-x42); GNW[43 * 128 + (c - 128)] = (bf16)f2bf(-x43); GNW[44 * 128 + (c - 128)] = (bf16)f2bf(-x44); GNW[45 * 128 + (c - 128)] = (bf16)f2bf(-x45); GNW[46 * 128 + (c - 128)] = (bf16)f2bf(-x46); GNW[47 * 128 + (c - 128)] = (bf16)f2bf(-x47); GNW[48 * 128 + (c - 128)] = (bf16)f2bf(-x48); GNW[49 * 128 + (c - 128)] = (bf16)f2bf(-x49); GNW[50 * 128 + (c - 128)] = (bf16)f2bf(-x50); GNW[51 * 128 + (c - 128)] = (bf16)f2bf(-x51); GNW[52 * 128 + (c - 128)] = (bf16)f2bf(-x52); GNW[53 * 128 + (c - 128)] = (bf16)f2bf(-x53); GNW[54 * 128 + (c - 128)] = (bf16)f2bf(-x54); GNW[55 * 128 + (c - 128)] = (bf16)f2bf(-x55); GNW[56 * 128 + (c - 128)] = (bf16)f2bf(-x56); GNW[57 * 128 + (c - 128)] = (bf16)f2bf(-x57); GNW[58 * 128 + (c - 128)] = (bf16)f2bf(-x58); GNW[59 * 128 + (c - 128)] = (bf16)f2bf(-x59); GNW[60 * 128 + (c - 128)] = (bf16)f2bf(-x60); GNW[61 * 128 + (c - 128)] = (bf16)f2bf(-x61); GNW[62 * 128 + (c - 128)] = (bf16)f2bf(-x62); GNW[63 * 128 + (c - 128)] = (bf16)f2bf(-x63); }
#undef GDN_RHS
#undef GDN_L4
    } else {
        const int t2 = tid - 256; const float gl = gcs[63];
        { const int i = t2 >> 2, d0 = (t2 & 3) * 32; const float e = __expf(gcs[i]);
#pragma unroll
          for (int x8 = 0; x8 < 4; ++x8) { const v4f a = *(const LAS v4f*)(qs + i * QP + d0 + 8 * x8), b = *(const LAS v4f*)(qs + i * QP + d0 + 8 * x8 + 4);
              v4u w; w.x = pk2(a.x * e, a.y * e); w.y = pk2(a.z * e, a.w * e); w.z = pk2(b.x * e, b.y * e); w.w = pk2(b.z * e, b.w * e); *(v4u*)(GQG + i * 128 + d0 + 8 * x8) = w; } }
        { const int d = t2 >> 1, j0 = (t2 & 1) * 32;
#pragma unroll
          for (int x8 = 0; x8 < 4; ++x8) { float o[8];
#pragma unroll
              for (int x = 0; x < 8; ++x) { const int j = j0 + 8 * x8 + x; o[x] = ks[j * QP + d] * __expf(gl - gcs[j]); }
              v4u w; w.x = pk2(o[0], o[1]); w.y = pk2(o[2], o[3]); w.z = pk2(o[4], o[5]); w.w = pk2(o[6], o[7]); *(v4u*)(GKT + d * 64 + j0 + 8 * x8) = w; } }
        if (t2 == 0) GDL[item] = __expf(gl);
    }
    __syncthreads();
}
struct GdnFrags { bf16x8_t nw[4], qg[4], at[2], kt[2][2]; float u[4]; float dl; };
__device__ __forceinline__ void gdn_load(GdnFrags& F, const Params& p, int item, int off128, int off64, int offk, int offu) {
    const bf16* GNW = (const bf16*)(p.ws + WS_GNW) + (size_t)item * 8192; const bf16* GQG = (const bf16*)(p.ws + WS_GQG) + (size_t)item * 8192;
    const bf16* GAT = (const bf16*)(p.ws + WS_GAT) + (size_t)item * 4096; const bf16* GKT = (const bf16*)(p.ws + WS_GKT) + (size_t)item * 8192; const float* GU = (const float*)(p.ws + WS_GU) + (size_t)item * 8192;
#pragma unroll
    for (int ks = 0; ks < 4; ++ks) { F.nw[ks] = *(const bf16x8_t*)(GNW + off128 + 32 * ks); F.qg[ks] = *(const bf16x8_t*)(GQG + off128 + 32 * ks); }
#pragma unroll
    for (int ks = 0; ks < 2; ++ks) { F.at[ks] = *(const bf16x8_t*)(GAT + off64 + 32 * ks); F.kt[0][ks] = *(const bf16x8_t*)(GKT + offk + 32 * ks); F.kt[1][ks] = *(const bf16x8_t*)(GKT + offk + 1024 + 32 * ks); }
#pragma unroll
    for (int r = 0; r < 4; ++r) F.u[r] = GU[offu + r * 128];
    F.dl = ((const float*)(p.ws + WS_GDL))[item];
}
constexpr int STP = 136, VNP = 72;
__device__ __forceinline__ void gdn_seq(const Params& p, LAS unsigned char* lds, int wgi, int wave, int lane) {
    const int u = wgi * 2 + (wave >> 2), wi = wave & 3, h = u >> 3, sl = u & 7, g = lane >> 4, c = lane & 15;
    LAS unsigned short* ST = (LAS unsigned short*)(lds + (wave >> 2) * 12288);
    LAS unsigned short* VNT = ST + 2 * 16 * STP;
    float* GO = (float*)(p.ws + WS_GO);
    const int off128 = (16 * wi + c) * 128 + 8 * g, off64 = (16 * wi + c) * 64 + 8 * g, offk = (32 * wi + c) * 64 + 8 * g, offu = (16 * wi + 4 * g) * 128 + 16 * sl + c;
#pragma unroll
    for (int mt = 0; mt < 2; ++mt) *(LAS v2u*)(ST + c * STP + 16 * (2 * wi + mt) + 4 * g) = (v2u){0u, 0u};
    pg8::f32x4 Sacc[2] = {{0.f, 0.f, 0.f, 0.f}, {0.f, 0.f, 0.f, 0.f}};
    __syncthreads();
    GdnFrags F0, F1;
    gdn_load(F0, p, h, off128, off64, offk, offu);
#define GDN_STEP(F, n_) do { const int cur = (n_) & 1; bf16x8_t sf[4]; \
        _Pragma("unroll") for (int ks = 0; ks < 4; ++ks) sf[ks] = *(const LAS bf16x8_t*)(ST + cur * 16 * STP + c * STP + 32 * ks + 8 * g); \
        pg8::f32x4 vn = {F.u[0], F.u[1], F.u[2], F.u[3]}; \
        _Pragma("unroll") for (int ks = 0; ks < 4; ++ks) vn = __builtin_amdgcn_mfma_f32_16x16x32_bf16(F.nw[ks], sf[ks], vn, 0, 0, 0); \
        { v2u w; w.x = pk2(vn[0], vn[1]); w.y = pk2(vn[2], vn[3]); *(LAS v2u*)(VNT + c * VNP + 16 * wi + 4 * g) = w; } \
        __syncthreads(); \
        const bf16x8_t v0 = *(const LAS bf16x8_t*)(VNT + c * VNP + 8 * g), v1 = *(const LAS bf16x8_t*)(VNT + c * VNP + 32 + 8 * g); \
        pg8::f32x4 o = {0.f, 0.f, 0.f, 0.f}; \
        _Pragma("unroll") for (int ks = 0; ks < 4; ++ks) o = __builtin_amdgcn_mfma_f32_16x16x32_bf16(F.qg[ks], sf[ks], o, 0, 0, 0); \
        o = __builtin_amdgcn_mfma_f32_16x16x32_bf16(F.at[0], v0, o, 0, 0, 0); o = __builtin_amdgcn_mfma_f32_16x16x32_bf16(F.at[1], v1, o, 0, 0, 0); \
        { const size_t tb = (size_t)(n_) * 64 + 16 * wi + 4 * g; _Pragma("unroll") for (int r = 0; r < 4; ++r) GO[(tb + r) * BW + h * 128 + 16 * sl + c] = o[r]; } \
        _Pragma("unroll") for (int mt = 0; mt < 2; ++mt) { Sacc[mt] = Sacc[mt] * F.dl; \
            Sacc[mt] = __builtin_amdgcn_mfma_f32_16x16x32_bf16(F.kt[mt][0], v0, Sacc[mt], 0, 0, 0); Sacc[mt] = __builtin_amdgcn_mfma_f32_16x16x32_bf16(F.kt[mt][1], v1, Sacc[mt], 0, 0, 0); \
            v2u w; w.x = pk2(Sacc[mt][0], Sacc[mt][1]); w.y = pk2(Sacc[mt][2], Sacc[mt][3]); *(LAS v2u*)(ST + (cur ^ 1) * 16 * STP + c * STP + 16 * (2 * wi + mt) + 4 * g) = w; } \
        __syncthreads(); } while (0)
    for (int n = 0; n < T / 64; n += 2) {
        gdn_load(F1, p, (n + 1) * 4 + h, off128, off64, offk, offu);
        GDN_STEP(F0, n);
        if (n + 2 < T / 64) gdn_load(F0, p, (n + 2) * 4 + h, off128, off64, offk, offu);
        GDN_STEP(F1, n + 1);
    }
#undef GDN_STEP
}

__device__ __forceinline__ void mixer_gmlp_item(const Params& p, int l, LAS unsigned char* lds, int item, int tid, int wave, int lane) {
    const int chunk = item >> 2, g = item & 3; const size_t tok0 = (size_t)chunk * 128;
    const bf16* Z = (const bf16*)(p.ws + WS_Z); bf16* BR1 = (bf16*)(p.ws + WS_BR) + (size_t)1 * T * BW;
    const float* ng = p.in[I_GMNG] + l * BW; const float* nb = p.in[I_GMNB] + l * BW;
    const float* wsp = p.in[I_GMWS] + ((size_t)(l * 4 + g) * 128) * 128; const float* bsp = p.in[I_GMBS] + (l * 4 + g) * 128;
    LAS float* vn = (LAS float*)lds;
    for (int r = 0; r < 16; ++r) { const int tk = wave * 16 + r;
        const v4u raw = *(const v4u*)(Z + (tok0 + tk) * ZC + ZC_GMV + 8 * lane); float x[8]; unpack8(raw, x); float s = 0.f;
#pragma unroll
        for (int i = 0; i < 8; ++i) { x[i] = gelu_tanh(x[i]); s += x[i]; }
        const float mean = wave_sum(s) * (1.f / 512.f); float ss = 0.f;
#pragma unroll
        for (int i = 0; i < 8; ++i) { x[i] -= mean; ss += x[i] * x[i]; }
        const float rstd = rsqrtf(wave_sum(ss) * (1.f / 512.f) + LN_EPS);
        if ((lane >> 4) == g) { const int cl = 8 * (lane & 15);
#pragma unroll
            for (int i = 0; i < 8; ++i) vn[tk * 128 + cl + i] = x[i] * rstd * ng[8 * lane + i] + nb[8 * lane + i]; }
    }
    __syncthreads();
    const int t = tid >> 2, cq = tid & 3; float acc[32];
#pragma unroll
    for (int i = 0; i < 32; ++i) acc[i] = 0.f;
    const float* wrow = wsp + (size_t)t * 128;
    for (int s = 0; s <= t; ++s) { const float w = wrow[s]; const LAS float* row = vn + s * 128 + cq * 32;
#pragma unroll
        for (int i4 = 0; i4 < 8; ++i4) { const v4f a = *(const LAS v4f*)(row + 4 * i4); acc[4 * i4] += w * a.x; acc[4 * i4 + 1] += w * a.y; acc[4 * i4 + 2] += w * a.z; acc[4 * i4 + 3] += w * a.w; } }
    const float bias = bsp[t];
#pragma unroll
    for (int i8 = 0; i8 < 4; ++i8) { const v4u raw = *(const v4u*)(Z + (tok0 + t) * ZC + ZC_GMU + g * 128 + cq * 32 + 8 * i8); float u[8]; unpack8(raw, u); float o[8];
#pragma unroll
        for (int i = 0; i < 8; ++i) o[i] = gelu_tanh(u[i]) * (acc[8 * i8 + i] + bias);
        v4u w; w.x = pk2(o[0], o[1]); w.y = pk2(o[2], o[3]); w.z = pk2(o[4], o[5]); w.w = pk2(o[6], o[7]);
        *(v4u*)(BR1 + (tok0 + t) * BW + g * 128 + cq * 32 + 8 * i8) = w; }
    __syncthreads();
}
__device__ __forceinline__ void mixer_sb_item(const Params& p, LAS float* qs  , int item, int lane) {
    const int h = item >> 11, t0 = (item & 2047) * 4;
    const bf16* Z = (const bf16*)(p.ws + WS_Z); bf16* BR0 = (bf16*)(p.ws + WS_BR);
#pragma unroll
    for (int qi = 0; qi < 4; ++qi) { const unsigned w = *(const unsigned*)(Z + (size_t)(t0 + qi) * ZC + ZC_SBQ + h * 128 + 2 * lane);
        qs[qi * 128 + 2 * lane] = bflo(w) * 0.08838834764831845f; qs[qi * 128 + 2 * lane + 1] = bfhi(w) * 0.08838834764831845f; }
    LDS_WAIT(); asm volatile("" ::: "memory");
    float acc[4][2], racc[4];
#pragma unroll
    for (int qi = 0; qi < 4; ++qi) { acc[qi][0] = 0.f; acc[qi][1] = 0.f; racc[qi] = 0.f; }
    for (int base = t0 + 2; base >= 0; base -= 64) {
        const int s = base - lane; const bool vk = s >= 0; const int sc = vk ? s : 0;
        float z[4] = {0.f, 0.f, 0.f, 0.f};
        const bf16* krow = Z + (size_t)sc * ZC + ZC_SBK + h * 128;
#pragma unroll 4
        for (int c = 0; c < 16; ++c) { const v4u raw = *(const v4u*)(krow + 8 * c); float kf[8]; unpack8(raw, kf);
#pragma unroll
            for (int qi = 0; qi < 4; ++qi) { const v4f q0 = *(const LAS v4f*)(qs + qi * 128 + 8 * c), q1 = *(const LAS v4f*)(qs + qi * 128 + 8 * c + 4);
                z[qi] += q0.x * kf[0] + q0.y * kf[1] + q0.z * kf[2] + q0.w * kf[3] + q1.x * kf[4] + q1.y * kf[5] + q1.z * kf[6] + q1.w * kf[7]; } }
        float a[4];
#pragma unroll
        for (int qi = 0; qi < 4; ++qi) { const bool m = vk && (s < t0 + qi); const float sp = m ? softplusf_(z[qi]) : 0.f;
            const float incl = wave_scan_incl(sp); const float tot = __builtin_bit_cast(float, __builtin_amdgcn_readlane(__builtin_bit_cast(int, incl), 63));
            a[qi] = m ? __expf(z[qi] - sp - (racc[qi] + (incl - sp))) : 0.f; racc[qi] += tot; }
#pragma unroll 8
        for (int kl = 0; kl < 64; ++kl) { int sk = base - kl; sk = sk < 0 ? 0 : sk;
            const unsigned w = *(const unsigned*)(Z + (size_t)sk * ZC + ZC_SBV + h * 128 + 2 * lane); const float v0 = bflo(w), v1 = bfhi(w);
#pragma unroll
            for (int qi = 0; qi < 4; ++qi) { const float aw = __builtin_bit_cast(float, __builtin_amdgcn_readlane(__builtin_bit_cast(int, a[qi]), kl)); acc[qi][0] += aw * v0; acc[qi][1] += aw * v1; } }
        if (fminf(fminf(racc[0], racc[1]), fminf(racc[2], racc[3])) > 104.f) break;
    }
#pragma unroll
    for (int qi = 0; qi < 4; ++qi) *(unsigned*)(BR0 + (size_t)(t0 + qi) * BW + h * 128 + 2 * lane) = pk2(acc[qi][0], acc[qi][1]);
}
__device__ __forceinline__ void phase_mixers(const Params& p, int l, LAS unsigned char* lds, int wg, int G, int tid, int wave, int lane, const XcdBarrier& bar) {
    if (wg < 16) { gdn_seq(p, lds, wg, wave, lane); return; }
    if (wg < 34) { ml_seq(p, lds, wg - 16, wave, lane); return; }
    const int w2 = wg - 34, G2 = G - 34;
    for (int it = w2; it < 256; it += G2) mixer_gmlp_item(p, l, lds, it, tid, wave, lane);
    LAS float* qs = (LAS float*)(lds + wave * 2048);
    for (int it = w2 * 8 + wave; it < 4 * 2048; it += G2 * 8) mixer_sb_item(p, qs, it, lane);
}

__device__ __forceinline__ void phase_post(const Params& p, int l, int gw, int NGW, int lane) {
    const bf16* Z = (const bf16*)(p.ws + WS_Z); const float* GO = (const float*)(p.ws + WS_GO); const float* HO = (const float*)(p.ws + WS_HO); const float* HDEN = (const float*)(p.ws + WS_HDEN);
    bf16* BR2 = (bf16*)(p.ws + WS_BR) + (size_t)2 * T * BW; bf16* BR3 = (bf16*)(p.ws + WS_BR) + (size_t)3 * T * BW;
    const float* gng = p.in[I_GDNNG] + l * 128; const float* mng = p.in[I_MLNG] + l * BW;
    for (int t = gw; t < T; t += NGW) {
        {   const v4f a0 = *(const v4f*)(GO + (size_t)t * BW + 8 * lane), a1 = *(const v4f*)(GO + (size_t)t * BW + 8 * lane + 4); float o[8] = {a0.x, a0.y, a0.z, a0.w, a1.x, a1.y, a1.z, a1.w}; float ss = 0.f;
#pragma unroll
            for (int i = 0; i < 8; ++i) ss += o[i] * o[i];
            const float r = rsqrtf(sum16(ss) * (1.f / 128.f) + LN_EPS);
            const v4u graw = *(const v4u*)(Z + (size_t)t * ZC + ZC_GDNG + 8 * lane); float gt[8]; unpack8(graw, gt);
#pragma unroll
            for (int i = 0; i < 8; ++i) o[i] = o[i] * r * gng[(8 * lane + i) & 127] * siluf_(gt[i]);
            v4u w; w.x = pk2(o[0], o[1]); w.y = pk2(o[2], o[3]); w.z = pk2(o[4], o[5]); w.w = pk2(o[6], o[7]); *(v4u*)(BR2 + (size_t)t * BW + 8 * lane) = w; }
        {   const v4f a0 = *(const v4f*)(HO + (size_t)t * BW + 8 * lane), a1 = *(const v4f*)(HO + (size_t)t * BW + 8 * lane + 4); float o[8] = {a0.x, a0.y, a0.z, a0.w, a1.x, a1.y, a1.z, a1.w}; float ss = 0.f;
            const float dn = 1.f / fmaxf(fabsf(HDEN[(size_t)t * 4 + (lane >> 4)]), 1.f);
#pragma unroll
            for (int i = 0; i < 8; ++i) { o[i] *= dn; ss += o[i] * o[i]; }
            const float r = rsqrtf(sum16(ss) * (1.f / 128.f) + LN_EPS);
            const v4u graw = *(const v4u*)(Z + (size_t)t * ZC + ZC_MLO + 8 * lane); float gt[8]; unpack8(graw, gt);
#pragma unroll
            for (int i = 0; i < 8; ++i) o[i] = o[i] * r * mng[8 * lane + i] * sigmoidf_(gt[i]);
            v4u w; w.x = pk2(o[0], o[1]); w.y = pk2(o[2], o[3]); w.z = pk2(o[4], o[5]); w.w = pk2(o[6], o[7]); *(v4u*)(BR3 + (size_t)t * BW + 8 * lane) = w; }
    }
}

__device__ __forceinline__ void ln_row(const float* yrow, const float* g, const float* b, int lane, v4f (&v)[8]) {
    const v4f* yr = (const v4f*)yrow + lane; float s = 0.f;
#pragma unroll
    for (int j = 0; j < 8; ++j) { v[j] = yr[64 * j]; s += (v[j].x + v[j].y) + (v[j].z + v[j].w); }
    const float mean = wave_sum(s) * (1.f / D); float s2 = 0.f;
#pragma unroll
    for (int j = 0; j < 8; ++j) { v[j] = v[j] - mean; s2 += (v[j].x * v[j].x + v[j].y * v[j].y) + (v[j].z * v[j].z + v[j].w * v[j].w); }
    const float rstd = rsqrtf(wave_sum(s2) * (1.f / D) + LN_EPS);
#pragma unroll
    for (int j = 0; j < 8; ++j) { const v4f gg = ((const v4f*)g)[lane + 64 * j], bb = ((const v4f*)b)[lane + 64 * j]; v[j] = v[j] * rstd * gg + bb; }
}
__device__ __forceinline__ void phase_ln1_router(const Params& p, int l, LAS unsigned char* lds, int wg, int G, int wave, int lane) {
    const float* Y = (const float*)(p.ws + WS_Y); float* X1 = (float*)(p.ws + WS_X1); bf16* X1B = (bf16*)(p.ws + WS_X1B); int* LIST = (int*)(p.ws + WS_LIST); float* WL = (float*)(p.ws + WS_WL); unsigned* SLOT = (unsigned*)(p.ws + WS_SLOT);
    unsigned* cnt = (unsigned*)(p.ws + WS_CTL) + CW_CNT + l * 4096;
    const float* g1 = p.in[I_LN1G] + (size_t)l * D; const float* b1 = p.in[I_LN1B] + (size_t)l * D;
    const float* wr = p.in[I_WR] + (size_t)l * D * NE; const float rbias = p.in[I_RB][l * NE + lane];
    LAS float* xt = (LAS float*)lds;
    LAS float* part = (LAS float*)(lds + 65536);
    for (int tl = wg; tl < T / 8; tl += G) {
        const size_t m = (size_t)tl * 8 + wave;
        {   v4f v[8]; ln_row(Y + m * D, g1, b1, lane, v);
            v4f* xo = (v4f*)(X1 + m * D) + lane; v2u* xb = (v2u*)(X1B + m * D) + lane;
#pragma unroll
            for (int j = 0; j < 8; ++j) { xo[64 * j] = v[j]; v2u o; o.x = pk2(v[j].x, v[j].y); o.y = pk2(v[j].z, v[j].w); xb[64 * j] = o; *(LAS v4f*)(xt + wave * D + 4 * lane + 256 * j) = v[j]; } }
        __syncthreads();
        {   float acc[8];
#pragma unroll
            for (int r = 0; r < 8; ++r) acc[r] = 0.f;
#pragma unroll 2
            for (int d4 = 0; d4 < 64; ++d4) { const int d = wave * 256 + 4 * d4;
                const float w0 = wr[(size_t)(d + 0) * NE + lane], w1 = wr[(size_t)(d + 1) * NE + lane], w2 = wr[(size_t)(d + 2) * NE + lane], w3 = wr[(size_t)(d + 3) * NE + lane];
#pragma unroll
                for (int r = 0; r < 8; ++r) { const v4f xv = *(const LAS v4f*)(xt + r * D + d); acc[r] += xv.x * w0 + xv.y * w1 + xv.z * w2 + xv.w * w3; } }
#pragma unroll
            for (int r = 0; r < 8; ++r) part[(wave * 8 + r) * 64 + lane] = acc[r]; }
        __syncthreads();
        {   float logit = 0.f;
#pragma unroll
            for (int w = 0; w < 8; ++w) logit += part[(w * 8 + wave) * 64 + lane];
            const float s = sigmoidf_(logit), biased = s + rbias;
            const float m1 = max8(biased); const float li = (float)(lane & 7);
            const float first = min8(biased == m1 ? li : 8.f);
            const float m2 = max8(li == first ? -INFINITY : biased);
            const float gs = m1 + m2; const int myg = lane >> 3; int grank = 0;
#pragma unroll
            for (int g2 = 0; g2 < 8; ++g2) { const float o = __builtin_bit_cast(float, __builtin_amdgcn_readlane(__builtin_bit_cast(int, gs), g2 * 8)); grank += (o > gs || (o == gs && g2 < myg)) ? 1 : 0; }
            const float masked = grank < 4 ? biased : -INFINITY; int rank = 0;
#pragma unroll
            for (int e2 = 0; e2 < 64; ++e2) { const float o = __builtin_bit_cast(float, __builtin_amdgcn_readlane(__builtin_bit_cast(int, masked), e2)); rank += (o > masked || (o == masked && e2 < lane)) ? 1 : 0; }
            const float wsel = rank < 6 ? s : 0.f; const float tot = wave_sum(wsel);
            if (rank < 6) { const unsigned pos = __hip_atomic_fetch_add(cnt + 64 * lane, 1u, __ATOMIC_RELAXED, __HIP_MEMORY_SCOPE_AGENT);
                LIST[lane * T + pos] = (int)m; WL[lane * T + pos] = wsel / tot * 2.5f; SLOT[m * 8 + rank] = ((unsigned)lane << 16) | pos; } }
        __syncthreads();
    }
}
__device__ __forceinline__ void phase_combine_ln2(const Params& p, int l, float* dst, int gw, int NGW, int lane) {
    const float* X1 = (const float*)(p.ws + WS_X1); const bf16* YE = (const bf16*)(p.ws + WS_YEXP); const unsigned* SLOT = (const unsigned*)(p.ws + WS_SLOT);
    const unsigned* cnt = (const unsigned*)(p.ws + WS_CTL) + CW_CNT + l * 4096;
    const float* g2 = p.in[I_LN2G] + (size_t)l * D; const float* b2 = p.in[I_LN2B] + (size_t)l * D;
    const int tiles = ((int)cnt[64 * lane] + 255) >> 8; const float incl = wave_scan_incl((float)tiles);
    const int toff = (int)incl - tiles;
    const int tsh = __builtin_amdgcn_readlane((int)incl, 63);
    for (int m = gw; m < T; m += NGW) {
        v4f v[8]; const v4f* xr = (const v4f*)(X1 + (size_t)m * D) + lane;
#pragma unroll
        for (int j = 0; j < 8; ++j) v[j] = xr[64 * j] * ALPHA;
#pragma unroll
        for (int k = 0; k < 7; ++k) { size_t row;
            if (k == 0) row = (size_t)tsh * 256 + m;
            else { const unsigned s = __builtin_amdgcn_readfirstlane(SLOT[(size_t)m * 8 + (k - 1)]); const int e = (int)(s >> 16); row = (size_t)__builtin_amdgcn_readlane(toff, e) * 256 + (s & 0xffffu); }
            const v2u* yr = (const v2u*)(YE + row * D) + lane;
#pragma unroll
            for (int j = 0; j < 8; ++j) { const v2u y = yr[64 * j]; v[j].x += bflo(y.x); v[j].y += bfhi(y.x); v[j].z += bflo(y.y); v[j].w += bfhi(y.y); } }
        float s = 0.f;
#pragma unroll
        for (int j = 0; j < 8; ++j) s += (v[j].x + v[j].y) + (v[j].z + v[j].w);
        const float mean = wave_sum(s) * (1.f / D); float s2 = 0.f;
#pragma unroll
        for (int j = 0; j < 8; ++j) { v[j] = v[j] - mean; s2 += (v[j].x * v[j].x + v[j].y * v[j].y) + (v[j].z * v[j].z + v[j].w * v[j].w); }
        const float rstd = rsqrtf(wave_sum(s2) * (1.f / D) + LN_EPS);
        v4f* xo = (v4f*)(dst + (size_t)m * D) + lane;
#pragma unroll
        for (int j = 0; j < 8; ++j) { const v4f gg = ((const v4f*)g2)[lane + 64 * j], bb = ((const v4f*)b2)[lane + 64 * j]; xo[64 * j] = v[j] * rstd * gg + bb; }
    }
}

constexpr int NPH = 11;
template <int l>
__device__ __forceinline__ void run_layer(const Params& p, LAS unsigned char* lds, const XcdBarrier& bar, int tid, int lane, int wave, int G, int wg, int gw, int NGW) {
    unsigned char* ws = p.ws;
    {
        const float* xin = (l == 0) ? p.in[I_X] : (const float*)(ws + WS_XCUR);
        float* xout = (l == NL - 1) ? p.out : (float*)(ws + WS_XCUR);
#ifndef PROBE_DUP
#define PROBE_DUP (-1)
#endif
#define REP(k) for (int _r = 0; _r < (PROBE_DUP == (k) ? 2 : 1); ++_r)
#ifndef PH_MASK
#define PH_MASK 0x7ff
#endif
#define RUN(k) (((PH_MASK >> (k)) & 1) && p.ph_lo <= l * NPH + (k) && l * NPH + (k) < p.ph_hi)
#define SEAM(k) do { if (l * NPH + (k) + 1 < p.ph_hi) xcd_barrier(bar); } while (0)
        if (RUN(0)) { REP(0) { phase_convert(p, l, lds, gw, NGW, wave, lane); phase_xprep(p, l, xin, lds, gw, NGW, tid, lane); } SEAM(0); }
        if (RUN(1)) { REP(1) { pg8::Gemm g{(const bf16*)(ws + WS_XB), (const bf16*)(ws + WS_WIN), T, ZC, D, D, D}; pg8::StaticOrder S; S.init(T, ZC, G, wg);
            pg8::EpiBf16<0> E{(bf16*)(ws + WS_Z), ZC, nullptr, 0, 0, 1.f};
            pg8::gemm_phase<pg8::EpiBf16<0>, pg8::StaticOrder, true, true>(lds, g, S, E); } SEAM(1); }
        if (RUN(2)) { REP(2) { for (int it = wg; it < 1024; it += G) { if (it < 512) gdn_pre_item(p, l, lds, it, tid, wave, lane); else ml_pre_item(p, l, lds, it - 512, tid, wave, lane); } } SEAM(2); }
        if (RUN(3)) { REP(3) { phase_mixers(p, l, lds, wg, G, tid, wave, lane, bar); } SEAM(3); }
        if (RUN(4)) { REP(4) { phase_post(p, l, gw, NGW, lane); } SEAM(4); }
        if (RUN(5)) { REP(5) { pg8::Gemm g{(const bf16*)(ws + WS_BR), (const bf16*)(ws + WS_WBR), 4 * T, 4 * D, BW, BW, BW}; MergeOrder S{G, wg};
            EpiMerge E{(const bf16*)(ws + WS_Z), (float*)(ws + WS_MTMP), (bf16*)(ws + WS_MSUM)};
            pg8::gemm_phase<EpiMerge, MergeOrder, true, true>(lds, g, S, E); } SEAM(5); }
        if (RUN(6)) { REP(6) { pg8::Gemm g{(const bf16*)(ws + WS_MSUM), (const bf16*)(ws + WS_WOUT), T, D, D, D, D}; pg8::StaticOrder S; S.init(T, D, G, wg);
            EpiResid E{xin, (float*)(ws + WS_Y)};
            pg8::gemm_phase<EpiResid, pg8::StaticOrder, true, true>(lds, g, S, E); } SEAM(6); }
        if (RUN(7)) { REP(7) { phase_ln1_router(p, l, lds, wg, G, wave, lane); } SEAM(7); }
        if (RUN(8)) { REP(8) { const unsigned* cnt = (const unsigned*)(ws + WS_CTL) + CW_CNT + l * 4096; MoeTab M(lds); moe_tables(M, cnt, tid, lane, wave);
            UpOrder S{M, 0}; S.n = up_order_build(M, (const int*)(ws + WS_LIST), (const float*)(ws + WS_WL), wg, G, tid);
            pg8::Gemm g{(const bf16*)(ws + WS_X1B), (const bf16*)(ws + WS_WUP), T, NEX * 1024, D, D, D};
            EpiGluSparse E{(LAS const float*)M.wt, (bf16*)(ws + WS_HB)};
            pg8::gemm_phase_gather<EpiGluSparse, UpOrder>(lds, g, S, E); } SEAM(8); }
        if (RUN(9)) { REP(9) { const unsigned* cnt = (const unsigned*)(ws + WS_CTL) + CW_CNT + l * 4096; MoeTab M(lds); moe_tables(M, cnt, tid, lane, wave);
            DownOrder S{M, G, wg, 8 * M.t[65]};
            pg8::Gemm g{(const bf16*)(ws + WS_HB), (const bf16*)(ws + WS_WDN), HROWS, NEX * D, ED, ED, ED};
            EpiYexp E{(bf16*)(ws + WS_YEXP)};
            pg8::gemm_phase<EpiYexp, DownOrder, true, true>(lds, g, S, E); } SEAM(9); }
        if (RUN(10)) { REP(10) { phase_combine_ln2(p, l, xout, gw, NGW, lane); } SEAM(10); }
#undef RUN
#undef SEAM
    }
}
__global__ void __launch_bounds__(512, 2) fwd_kernel(Params p) {
    extern __shared__ __attribute__((aligned(16))) unsigned char lds_raw[];
    LAS unsigned char* lds = (LAS unsigned char*)lds_raw;
    const int tid = threadIdx.x, lane = tid & 63, wave = __builtin_amdgcn_readfirstlane(tid >> 6);
    const int G = gridDim.x, wg = blockIdx.x, gw = wg * 8 + wave, NGW = G * 8;
    volatile LAS unsigned* MISC = (volatile LAS unsigned*)(lds + MISC_OFF);
    if (tid < 32) MISC[tid] = 0u;
    __syncthreads();
    unsigned* ctl = (unsigned*)(p.ws + WS_CTL);
    const bool multi = (p.ph_hi - p.ph_lo) > 1;
    XcdBarrier bar; bar.bar = ctl + CW_BAR; bar.x = 0; bar.st = nullptr;
    if (multi) bar = xcd_barrier_post(ctl + CW_BAR, MISC + 8);
    run_layer<0>(p, lds, bar, tid, lane, wave, G, wg, gw, NGW);
    run_layer<1>(p, lds, bar, tid, lane, wave, G, wg, gw, NGW);
}

#ifndef MK_MULTI_LAUNCH
#define MK_MULTI_LAUNCH 0
#endif
extern "C" void kernel_launch(void* const* d_in, const int* in_sizes, int n_in, void* d_out, int out_size, void* d_ws, size_t ws_size, hipStream_t stream) {
    static int grid = 0;
    if (grid == 0) {
        if (n_in != 27 || out_size != T * D || ws_size < WS_END) { fprintf(stderr, "kernel_launch: unexpected shapes (n_in %d out %d ws %zu need %zu)\n", n_in, out_size, ws_size, (size_t)WS_END); grid = -1; return; }
        int dev = 0, cus = 0, per_cu = 0;
        if (hipGetDevice(&dev) != hipSuccess || hipDeviceGetAttribute(&cus, hipDeviceAttributeMultiprocessorCount, dev) != hipSuccess) { grid = -1; return; }
        if (hipFuncSetAttribute((const void*)fwd_kernel, hipFuncAttributeMaxDynamicSharedMemorySize, LDS_BYTES) != hipSuccess) { fprintf(stderr, "kernel_launch: hipFuncSetAttribute failed\n"); grid = -1; return; }
        if (hipOccupancyMaxActiveBlocksPerMultiprocessor(&per_cu, (const void*)fwd_kernel, 512, LDS_BYTES) != hipSuccess || per_cu < 1) { fprintf(stderr, "kernel_launch: occupancy query says %d\n", per_cu); }
        (void)hipGetLastError();
        grid = cus;
    }
    if (grid < 0) return;
    (void)hipMemsetAsync((char*)d_ws + WS_CTL, 0, CTL_ZERO_BYTES, stream);
    Params p{};
    for (int i = 0; i < 27; ++i) p.in[i] = (const float*)d_in[i];
    p.out = (float*)d_out; p.ws = (unsigned char*)d_ws;
#if MK_MULTI_LAUNCH
    for (int ph = 0; ph < NL * NPH; ++ph) { p.ph_lo = ph; p.ph_hi = ph + 1; hipLaunchKernelGGL(fwd_kernel, dim3(grid), dim3(512), LDS_BYTES, stream, p); }
#else
    p.ph_lo = 0; p.ph_hi = NL * NPH; hipLaunchKernelGGL(fwd_kernel, dim3(grid), dim3(512), LDS_BYTES, stream, p);
#endif
}
```

```cpp
#include <hip/hip_runtime.h>
#include <cstdio>
#include <cstdint>
#include <type_traits>
namespace pg8 {
#define PG8_LAS __attribute__((address_space(3)))
typedef unsigned short bf16_t;
typedef short bf16x8 __attribute__((ext_vector_type(8)));
typedef float f32x4 __attribute__((ext_vector_type(4)));
typedef unsigned u32x4 __attribute__((ext_vector_type(4)));
constexpr int BM = 256, BK = 64, HALF = 128, HTB = HALF * BK * 2  , STAGE_BYTES = 8 * HTB, NXCD = 8, WGM = 8;

__host__ __device__ __forceinline__ int lds_byte(int r, int c) { const int st = (r >> 4) * 2 + (c >> 5), rr = r & 15, cc = c & 31, ob = rr * 64 + cc * 2; return st * 1024 + (ob ^ (((ob >> 9) & 1) << 5)); }
__host__ __device__ __forceinline__ void stage_rc(int b, int& R, int& C) { const int st = b / 1024, sb = b % 1024, swz = sb ^ (((sb >> 9) & 1) << 5); R = (st >> 1) * 16 + swz / 64; C = (st & 1) * 32 + (swz % 64) / 2; }
__host__ __device__ __forceinline__ int perm32(int rho) { const int n = rho >> 4, i = rho & 15; return 8 * (i >> 2) + 4 * n + (i & 3); }

struct Unit { int pm, pn, aux; };
struct Gemm { const bf16_t* A; const bf16_t* Bt; int M, N, K, lda, ldb; };

struct StaticOrder {
    int nM, nN, nwg, G, c;
    __host__ __device__ void init(int M, int N, int G_, int c_) { nM = M / BM; nN = N / BM; nwg = nM * nN; G = G_; c = c_; }
    __host__ __device__ bool next(int i, Unit& u) const {
        const long L = (long)i * G + c; if (L >= nwg) return false;
        int wgid = (int)L; { const int q = nwg / NXCD, r = nwg % NXCD, xcd = wgid % NXCD, off = wgid / NXCD; wgid = (xcd < r ? xcd * (q + 1) : r * (q + 1) + (xcd - r) * q) + off; }
        const int nig = WGM * nN, gid = wgid / nig, fm = gid * WGM, gsz = (nM - fm) < WGM ? (nM - fm) : WGM;
        u.pm = fm + ((wgid % nig) % gsz); u.pn = (wgid % nig) / gsz; return true;
    }
    __device__ __forceinline__ void a_ready(const Unit&) const {}
    __device__ __forceinline__ void done(const Unit&) const {}
};

__device__ __forceinline__ unsigned cvt_pk_bf16(float lo, float hi) { unsigned r; asm volatile("v_cvt_pk_bf16_f32 %0, %1, %2" : "=v"(r) : "v"(lo), "v"(hi)); return r; }
typedef float f32x2 __attribute__((ext_vector_type(2)));
__device__ __forceinline__ f32x2 gelu_pk(f32x2 v) {
    const f32x2 av = __builtin_elementwise_abs(v), d = av * 0.2316418882f + 1.0f;
    f32x2 t; t.x = __builtin_amdgcn_rcpf(d.x); t.y = __builtin_amdgcn_rcpf(d.y);
    f32x2 q = t * 0.5307027145f + (-0.7265760135f); q = q * t + 0.7107068705f; q = q * t + (-0.142248368f); q = q * t + 0.127414796f; q = q * t;
    const f32x2 s = (v * v) * (-0.72134752044f);
    f32x2 e; e.x = __builtin_amdgcn_exp2f(s.x); e.y = __builtin_amdgcn_exp2f(s.y);
    const f32x2 m = v * (q * e), r = v - m;
    f32x2 o; o.x = v.x < 0.f ? m.x : r.x; o.y = v.y < 0.f ? m.y : r.y; return o;
}

template <int ACT  > struct EpiBf16 {
    static constexpr bool PERM = true, AFTER_DRAIN = false; static_assert(ACT == 0 || ACT == 1, "EpiBf16: ACT is 0 (none) or 1 (gelu_pk)");
    bf16_t* O; int ldc; const float* bias; int split_cols; size_t split_stride; float scale0;
    __device__ __forceinline__ void operator()(const f32x4 (&acc)[2][2][4][2], const Unit& u, int wr, int wc, int fr, int fq) const {
        const int row0 = u.pm * BM + wr * 64 + fr; int colt = u.pn * BM; bf16_t* base = O;
        float sc = 1.f; if (split_cols) { const int t = colt / split_cols; base += (size_t)t * split_stride; colt -= t * split_cols; if (t == 0) sc = scale0; }
        const int col0 = colt + wc * 32 + 8 * fq, bcol0 = u.pn * BM + wc * 32 + 8 * fq;
        f32x4 bv[2][2];
#pragma unroll
        for (int bj = 0; bj < 2; ++bj)
#pragma unroll
            for (int n = 0; n < 2; ++n) bv[bj][n] = bias ? *(const f32x4*)(bias + bcol0 + bj * HALF + 4 * n) : (f32x4){0.f, 0.f, 0.f, 0.f};
#pragma unroll
        for (int ai = 0; ai < 2; ++ai)
#pragma unroll
            for (int m = 0; m < 4; ++m) { bf16_t* rowp = base + (size_t)(row0 + ai * HALF + m * 16) * ldc + col0;
#pragma unroll
                for (int bj = 0; bj < 2; ++bj) { f32x4 v0 = acc[ai][bj][m][0] + bv[bj][0], v1 = acc[ai][bj][m][1] + bv[bj][1];
                    if (ACT == 1) { f32x2 a = gelu_pk((f32x2){v0[0], v0[1]}), b = gelu_pk((f32x2){v0[2], v0[3]}), c = gelu_pk((f32x2){v1[0], v1[1]}), d = gelu_pk((f32x2){v1[2], v1[3]});
                        v0 = (f32x4){a.x, a.y, b.x, b.y}; v1 = (f32x4){c.x, c.y, d.x, d.y}; }
                    v0 = v0 * sc; v1 = v1 * sc; u32x4 w; w.x = cvt_pk_bf16(v0[0], v0[1]); w.y = cvt_pk_bf16(v0[2], v0[3]); w.z = cvt_pk_bf16(v1[0], v1[1]); w.w = cvt_pk_bf16(v1[2], v1[3]);
                    *(u32x4*)(rowp + bj * HALF) = w; } }
    }
};

template <class Epi, class Sched, bool ALIGN_EPI = false, bool SP2 = false>
__device__ __forceinline__ void gemm_phase(PG8_LAS unsigned char* lds, const Gemm g, const Sched& S, const Epi& E) {
    const int tid = threadIdx.x, wid = __builtin_amdgcn_readfirstlane(tid >> 6), lane = tid & 63, wr = wid >> 2, wc = wid & 3, fr = lane & 15, fq = lane >> 4;
    const int K = g.K, nt = K / BK;
    unsigned voffA[2], voffB[2];
#pragma unroll
    for (int i = 0; i < 2; ++i) { int R, C; stage_rc(tid * 16 + i * 8192, R, C); const int Rb = Epi::PERM ? ((R & ~31) + perm32(R & 31)) : R;
        voffA[i] = (unsigned)(R * g.lda + C) * 2u; voffB[i] = (unsigned)(Rb * g.ldb + C) * 2u; }
    const size_t kstep = (size_t)(BK * 2);
    const size_t hstepA = (size_t)HALF * g.lda * 2, hstepB = (size_t)HALF * g.ldb * 2;
    const size_t tstepA = 2 * hstepA, tstepB = 2 * hstepB;
    const unsigned ldsw = (unsigned)wid * 1024u;
    const int aoff = lds_byte(wr * 64 + fr, fq * 8), boff = lds_byte(wc * 32 + fr, fq * 8);
#define PG8_SA(b, h) (((b) * 2 + (h)) * HTB)
#define PG8_SB(b, h) ((4 + (b) * 2 + (h)) * HTB)
#define PG8_STAGE(bufoff, gbase, voff) do { _Pragma("unroll") for (int _i = 0; _i < 2; ++_i) \
        __builtin_amdgcn_global_load_lds((const unsigned*)((const char*)(gbase) + (voff)[_i]), (PG8_LAS unsigned*)(lds + (bufoff) + ldsw + _i * 8192), 16, 0, 0); } while (0)
#define PG8_LDA(dst, b, h) do { _Pragma("unroll") for (int m = 0; m < 4; ++m) _Pragma("unroll") for (int k = 0; k < 2; ++k) dst[m][k] = *(const PG8_LAS bf16x8*)(lds + PG8_SA(b, h) + aoff + m * 2048 + k * 1024); } while (0)
#define PG8_LDB(dst, b, h) do { _Pragma("unroll") for (int n = 0; n < 2; ++n) _Pragma("unroll") for (int k = 0; k < 2; ++k) dst[n][k] = *(const PG8_LAS bf16x8*)(lds + PG8_SB(b, h) + boff + n * 2048 + k * 1024); } while (0)
#define PG8_MMA(ai, bj, At, Bt) do { __builtin_amdgcn_s_setprio(1); _Pragma("unroll") for (int m = 0; m < 4; ++m) _Pragma("unroll") for (int n = 0; n < 2; ++n) _Pragma("unroll") for (int k = 0; k < 2; ++k) \
        acc[ai][bj][m][n] = __builtin_amdgcn_mfma_f32_16x16x32_bf16(Bt[n][k], At[m][k], acc[ai][bj][m][n], 0, 0, 0); __builtin_amdgcn_s_setprio(0); } while (0)
#define PG8_WAIT_V(n) asm volatile("s_waitcnt vmcnt(" #n ")" ::: "memory")
#define PG8_WAIT_L(n) asm volatile("s_waitcnt lgkmcnt(" #n ")" ::: "memory")
#define PG8_BAR __builtin_amdgcn_s_barrier()
#define PG8_SCHED __builtin_amdgcn_sched_barrier(0)
    Unit cur, nxt; int ui = 0;
    if (!S.next(0, cur)) return;
    f32x4 acc[2][2][4][2];
#pragma unroll
    for (int a = 0; a < 2; ++a)
#pragma unroll
        for (int b = 0; b < 2; ++b)
#pragma unroll
            for (int m = 0; m < 4; ++m)
#pragma unroll
                for (int n = 0; n < 2; ++n) acc[a][b][m][n] = (f32x4){0.f, 0.f, 0.f, 0.f};
    bf16x8 At[4][2], B0[2][2], B1[2][2];
    const char* cA = (const char*)g.A + (size_t)cur.pm * tstepA; const char* cB = (const char*)g.Bt + (size_t)cur.pn * tstepB;
    S.a_ready(cur);
    if constexpr (SP2) {
        PG8_STAGE(PG8_SB(0, 0), cB, voffB); PG8_STAGE(PG8_SB(0, 1), cB + hstepB, voffB); PG8_STAGE(PG8_SA(0, 0), cA, voffA); PG8_STAGE(PG8_SA(0, 1), cA + hstepA, voffA);
        if (wr == 1) PG8_BAR;
        PG8_WAIT_V(2); PG8_BAR;
        PG8_STAGE(PG8_SB(1, 0), cB + kstep, voffB); PG8_STAGE(PG8_SA(1, 0), cA + kstep, voffA); PG8_STAGE(PG8_SB(1, 1), cB + hstepB + kstep, voffB);
        PG8_WAIT_V(6); PG8_BAR;
    } else {
        PG8_STAGE(PG8_SB(0, 0), cB, voffB); PG8_STAGE(PG8_SA(0, 0), cA, voffA); PG8_STAGE(PG8_SB(0, 1), cB + hstepB, voffB); PG8_STAGE(PG8_SA(0, 1), cA + hstepA, voffA);
        if (wr == 1) PG8_BAR;
        PG8_WAIT_V(4); PG8_BAR;
        PG8_STAGE(PG8_SB(1, 0), cB + kstep, voffB); PG8_STAGE(PG8_SA(1, 0), cA + kstep, voffA); PG8_STAGE(PG8_SB(1, 1), cB + hstepB + kstep, voffB);
        PG8_WAIT_V(6); PG8_BAR;
    }
    for (;;) {
        const bool has_next = S.next(ui + 1, nxt);
        const char* nA = has_next ? (const char*)g.A + (size_t)nxt.pm * tstepA : cA; const char* nB = has_next ? (const char*)g.Bt + (size_t)nxt.pn * tstepB : cB;
        for (int t = 0; t < nt; t += 2) {
            const bool last = (t == nt - 2);
            const char* a1 = cA + (size_t)(t + 1) * kstep;
            const char* a2 = last ? nA : cA + (size_t)(t + 2) * kstep; const char* b2 = last ? nB : cB + (size_t)(t + 2) * kstep;
            const char* a3 = a2 + kstep; const char* b3 = b2 + kstep;
            if (last && has_next) S.a_ready(nxt);
            if constexpr (SP2) {
            PG8_LDB(B0, 0, 0); PG8_LDB(B1, 0, 1); PG8_SCHED; PG8_LDA(At, 0, 0); PG8_STAGE(PG8_SA(1, 1), a1 + hstepA, voffA);
            PG8_WAIT_V(8); PG8_WAIT_L(0); PG8_BAR; PG8_MMA(0, 0, At, B0); PG8_MMA(0, 1, At, B1); PG8_BAR; PG8_SCHED;
            PG8_LDA(At, 0, 1); PG8_STAGE(PG8_SB(0, 0), b2, voffB); PG8_STAGE(PG8_SB(0, 1), b2 + hstepB, voffB); PG8_STAGE(PG8_SA(0, 0), a2, voffA);
            PG8_WAIT_V(8); PG8_WAIT_L(0); PG8_BAR; PG8_MMA(1, 0, At, B0); PG8_MMA(1, 1, At, B1); PG8_BAR; PG8_SCHED;
            PG8_LDB(B0, 1, 0); PG8_LDB(B1, 1, 1); PG8_SCHED; PG8_LDA(At, 1, 0); PG8_STAGE(PG8_SA(0, 1), a2 + hstepA, voffA);
            PG8_WAIT_V(8); PG8_WAIT_L(0); PG8_BAR; PG8_MMA(0, 0, At, B0); PG8_MMA(0, 1, At, B1); PG8_BAR; PG8_SCHED;
            PG8_LDA(At, 1, 1); PG8_STAGE(PG8_SB(1, 0), b3, voffB); PG8_STAGE(PG8_SB(1, 1), b3 + hstepB, voffB); PG8_STAGE(PG8_SA(1, 0), a3, voffA);
            PG8_WAIT_V(8); PG8_WAIT_L(0); PG8_BAR; PG8_MMA(1, 0, At, B0); PG8_MMA(1, 1, At, B1); PG8_BAR; PG8_SCHED;
            } else {
            PG8_LDB(B0, 0, 0); PG8_SCHED; PG8_LDA(At, 0, 0); PG8_STAGE(PG8_SA(1, 1), a1 + hstepA, voffA);
            PG8_WAIT_L(8); PG8_BAR; PG8_WAIT_L(0); PG8_MMA(0, 0, At, B0); PG8_BAR; PG8_SCHED;
            PG8_LDB(B1, 0, 1); PG8_STAGE(PG8_SB(0, 0), b2, voffB);
            PG8_BAR; PG8_WAIT_L(0); PG8_MMA(0, 1, At, B1); PG8_BAR;
            PG8_LDA(At, 0, 1); PG8_STAGE(PG8_SA(0, 0), a2, voffA);
            PG8_BAR; PG8_WAIT_L(0); PG8_MMA(1, 0, At, B0); PG8_BAR; PG8_SCHED;
            PG8_STAGE(PG8_SB(0, 1), b2 + hstepB, voffB);
            PG8_WAIT_V(6); PG8_BAR; PG8_MMA(1, 1, At, B1); PG8_BAR;
            PG8_LDB(B0, 1, 0); PG8_SCHED; PG8_LDA(At, 1, 0); PG8_STAGE(PG8_SA(0, 1), a2 + hstepA, voffA);
            PG8_WAIT_L(8); PG8_BAR; PG8_WAIT_L(0); PG8_MMA(0, 0, At, B0); PG8_BAR; PG8_SCHED;
            PG8_LDB(B1, 1, 1); PG8_STAGE(PG8_SB(1, 0), b3, voffB);
            PG8_BAR; PG8_WAIT_L(0); PG8_MMA(0, 1, At, B1); PG8_BAR;
            PG8_LDA(At, 1, 1); PG8_STAGE(PG8_SA(1, 0), a3, voffA);
            PG8_BAR; PG8_WAIT_L(0); PG8_MMA(1, 0, At, B0); PG8_BAR; PG8_SCHED;
            PG8_STAGE(PG8_SB(1, 1), b3 + hstepB, voffB);
            PG8_WAIT_V(6); PG8_BAR; PG8_MMA(1, 1, At, B1); PG8_BAR;
            }
        }
        if constexpr (ALIGN_EPI) { if (wr == 0) PG8_BAR; }
        if constexpr (!Epi::AFTER_DRAIN) { E(acc, cur, wr, wc, fr, fq); S.done(cur); }
        if (!has_next) break;
#pragma unroll
        for (int a = 0; a < 2; ++a)
#pragma unroll
            for (int b = 0; b < 2; ++b)
#pragma unroll
                for (int m = 0; m < 4; ++m)
#pragma unroll
                    for (int n = 0; n < 2; ++n) acc[a][b][m][n] = (f32x4){0.f, 0.f, 0.f, 0.f};
        cur = nxt; cA = nA; cB = nB; ++ui;
        if constexpr (ALIGN_EPI) { if (wr == 1) PG8_BAR; }
    }
    PG8_WAIT_V(0);
    if constexpr (!ALIGN_EPI) { if (wr == 0) PG8_BAR; }
    PG8_BAR;
    if constexpr (Epi::AFTER_DRAIN) { E.fused(acc, cur, wr, wc, fr, fq, lds, wid, lane); S.done(cur); }
#undef PG8_SA
#undef PG8_SB
#undef PG8_STAGE
#undef PG8_LDA
#undef PG8_LDB
#undef PG8_MMA
#undef PG8_WAIT_V
#undef PG8_WAIT_L
#undef PG8_BAR
#undef PG8_SCHED
}
template <class Epi, class Sched>
__device__ __forceinline__ void gemm_phase_gather(PG8_LAS unsigned char* lds, const Gemm g, const Sched& S, const Epi& E) {
    const int tid = threadIdx.x, wid = __builtin_amdgcn_readfirstlane(tid >> 6), lane = tid & 63, wr = wid >> 2, wc = wid & 3, fr = lane & 15, fq = lane >> 4;
    const int K = g.K, nt = K / BK;
    unsigned voffB[2]; int RA[2], CA[2];
#pragma unroll
    for (int i = 0; i < 2; ++i) { int R, C; stage_rc(tid * 16 + i * 8192, R, C); const int Rb = Epi::PERM ? ((R & ~31) + perm32(R & 31)) : R;
        RA[i] = R; CA[i] = C; voffB[i] = (unsigned)(Rb * g.ldb + C) * 2u; }
    const size_t kstep = (size_t)(BK * 2);
    const size_t hstepB = (size_t)HALF * g.ldb * 2, tstepB = 2 * hstepB;
    const unsigned ldsw = (unsigned)wid * 1024u;
    const int aoff = lds_byte(wr * 64 + fr, fq * 8), boff = lds_byte(wc * 32 + fr, fq * 8);
#define PG8_SA(b, h) (((b) * 2 + (h)) * HTB)
#define PG8_SB(b, h) ((4 + (b) * 2 + (h)) * HTB)
#define PG8_STAGE(bufoff, gbase, voff) do { _Pragma("unroll") for (int _i = 0; _i < 2; ++_i) \
        __builtin_amdgcn_global_load_lds((const unsigned*)((const char*)(gbase) + (voff)[_i]), (PG8_LAS unsigned*)(lds + (bufoff) + ldsw + _i * 8192), 16, 0, 0); } while (0)
#define PG8_LDA(dst, b, h) do { _Pragma("unroll") for (int m = 0; m < 4; ++m) _Pragma("unroll") for (int k = 0; k < 2; ++k) dst[m][k] = *(const PG8_LAS bf16x8*)(lds + PG8_SA(b, h) + aoff + m * 2048 + k * 1024); } while (0)
#define PG8_LDB(dst, b, h) do { _Pragma("unroll") for (int n = 0; n < 2; ++n) _Pragma("unroll") for (int k = 0; k < 2; ++k) dst[n][k] = *(const PG8_LAS bf16x8*)(lds + PG8_SB(b, h) + boff + n * 2048 + k * 1024); } while (0)
#define PG8_MMA(ai, bj, At, Bt) do { __builtin_amdgcn_s_setprio(1); _Pragma("unroll") for (int m = 0; m < 4; ++m) _Pragma("unroll") for (int n = 0; n < 2; ++n) _Pragma("unroll") for (int k = 0; k < 2; ++k) \
        acc[ai][bj][m][n] = __builtin_amdgcn_mfma_f32_16x16x32_bf16(Bt[n][k], At[m][k], acc[ai][bj][m][n], 0, 0, 0); __builtin_amdgcn_s_setprio(0); } while (0)
#define PG8_WAIT_V(n) asm volatile("s_waitcnt vmcnt(" #n ")" ::: "memory")
#define PG8_WAIT_L(n) asm volatile("s_waitcnt lgkmcnt(" #n ")" ::: "memory")
#define PG8_BAR __builtin_amdgcn_s_barrier()
#define PG8_SCHED __builtin_amdgcn_sched_barrier(0)
#define PG8_ROWS(dst, ui_) do { _Pragma("unroll") for (int _h = 0; _h < 2; ++_h) _Pragma("unroll") for (int _i = 0; _i < 2; ++_i) \
        dst[_h][_i] = (unsigned)S.row_token((ui_), _h * HALF + RA[_i]) * (unsigned)(g.lda * 2) + (unsigned)(CA[_i] * 2); } while (0)
    Unit cur, nxt; int ui = 0;
    if (!S.next(0, cur)) return;
    f32x4 acc[2][2][4][2];
#pragma unroll
    for (int a = 0; a < 2; ++a)
#pragma unroll
        for (int b = 0; b < 2; ++b)
#pragma unroll
            for (int m = 0; m < 4; ++m)
#pragma unroll
                for (int n = 0; n < 2; ++n) acc[a][b][m][n] = (f32x4){0.f, 0.f, 0.f, 0.f};
    bf16x8 At[4][2], B0[2][2], B1[2][2];
    unsigned offC[2][2];
    PG8_ROWS(offC, 0);
    const char* gA = (const char*)g.A;
    const char* cB = (const char*)g.Bt + (size_t)cur.pn * tstepB;
    PG8_STAGE(PG8_SB(0, 0), cB, voffB); PG8_STAGE(PG8_SB(0, 1), cB + hstepB, voffB); PG8_STAGE(PG8_SA(0, 0), gA, offC[0]); PG8_STAGE(PG8_SA(0, 1), gA, offC[1]);
    if (wr == 1) PG8_BAR;
    PG8_WAIT_V(2); PG8_BAR;
    PG8_STAGE(PG8_SB(1, 0), cB + kstep, voffB); PG8_STAGE(PG8_SA(1, 0), gA + kstep, offC[0]); PG8_STAGE(PG8_SB(1, 1), cB + hstepB + kstep, voffB);
    PG8_WAIT_V(6); PG8_BAR;
    for (;;) {
        const bool has_next = S.next(ui + 1, nxt);
        const char* nB = has_next ? (const char*)g.Bt + (size_t)nxt.pn * tstepB : cB;
        for (int t = 0; t < nt; t += 2) {
            const bool last = (t == nt - 2);
            const char* a1 = gA + (size_t)(t + 1) * kstep;
            const char* a2 = last ? gA : gA + (size_t)(t + 2) * kstep; const char* b2 = last ? nB : cB + (size_t)(t + 2) * kstep;
            const char* a3 = a2 + kstep; const char* b3 = b2 + kstep;
            PG8_LDB(B0, 0, 0); PG8_LDB(B1, 0, 1); PG8_SCHED; PG8_LDA(At, 0, 0); PG8_STAGE(PG8_SA(1, 1), a1, offC[1]);
            if (last && has_next) { PG8_ROWS(offC, ui + 1); }
            PG8_WAIT_V(8); PG8_WAIT_L(0); PG8_BAR; PG8_MMA(0, 0, At, B0); PG8_MMA(0, 1, At, B1); PG8_BAR; PG8_SCHED;
            PG8_LDA(At, 0, 1); PG8_STAGE(PG8_SB(0, 0), b2, voffB); PG8_STAGE(PG8_SB(0, 1), b2 + hstepB, voffB); PG8_STAGE(PG8_SA(0, 0), a2, offC[0]);
            PG8_WAIT_V(8); PG8_WAIT_L(0); PG8_BAR; PG8_MMA(1, 0, At, B0); PG8_MMA(1, 1, At, B1); PG8_BAR; PG8_SCHED;
            PG8_LDB(B0, 1, 0); PG8_LDB(B1, 1, 1); PG8_SCHED; PG8_LDA(At, 1, 0); PG8_STAGE(PG8_SA(0, 1), a2, offC[1]);
            PG8_WAIT_V(8); PG8_WAIT_L(0); PG8_BAR; PG8_MMA(0, 0, At, B0); PG8_MMA(0, 1, At, B1); PG8_BAR; PG8_SCHED;
            PG8_LDA(At, 1, 1); PG8_STAGE(PG8_SB(1, 0), b3, voffB); PG8_STAGE(PG8_SB(1, 1), b3 + hstepB, voffB); PG8_STAGE(PG8_SA(1, 0), a3, offC[0]);
            PG8_WAIT_V(8); PG8_WAIT_L(0); PG8_BAR; PG8_MMA(1, 0, At, B0); PG8_MMA(1, 1, At, B1); PG8_BAR; PG8_SCHED;
        }
        if (wr == 0) PG8_BAR;
        E(acc, cur, wr, wc, fr, fq); S.done(cur);
        if (!has_next) break;
#pragma unroll
        for (int a = 0; a < 2; ++a)
#pragma unroll
            for (int b = 0; b < 2; ++b)
#pragma unroll
                for (int m = 0; m < 4; ++m)
#pragma unroll
                    for (int n = 0; n < 2; ++n) acc[a][b][m][n] = (f32x4){0.f, 0.f, 0.f, 0.f};
        cur = nxt; cB = nB; ++ui;
        if (wr == 1) PG8_BAR;
    }
    PG8_WAIT_V(0);
    PG8_BAR;
#undef PG8_ROWS
#undef PG8_SA
#undef PG8_SB
#undef PG8_STAGE
#undef PG8_LDA
#undef PG8_LDB
#undef PG8_MMA
#undef PG8_WAIT_V
#undef PG8_WAIT_L
#undef PG8_BAR
#undef PG8_SCHED
}
}

constexpr int T = 8192, D = 2048, NL = 2, BW = 512, ZC = 14336, INC = 14352;
constexpr int NE = 64, NEX = 65  , ED = 512;
constexpr int HK = NEX * ED;
constexpr float ALPHA = 1.41421356237f;
constexpr float LN_EPS = 1e-5f;
constexpr int ZC_SBQ = 0, ZC_SBK = 512, ZC_SBV = 1024, ZC_GMU = 1536, ZC_GMV = 2048, ZC_GDN = 2560, ZC_GDNG = 4096,
              ZC_MLQ = 4608, ZC_MLK = 4864, ZC_MLV = 5120, ZC_MLO = 5632, ZC_GATE = 6144;

#define GAS __attribute__((address_space(1)))
#define LAS __attribute__((address_space(3)))
typedef unsigned short bf16;
typedef unsigned v4u __attribute__((ext_vector_type(4)));
typedef unsigned v2u __attribute__((ext_vector_type(2)));
typedef float v4f __attribute__((ext_vector_type(4)));
typedef float v2f __attribute__((ext_vector_type(2)));
#define LDS_WAIT() asm volatile("s_waitcnt lgkmcnt(0)" ::: "memory")
#define LDS_BAR() do { asm volatile("s_waitcnt lgkmcnt(0)" ::: "memory"); __builtin_amdgcn_s_barrier(); asm volatile("" ::: "memory"); } while (0)

constexpr size_t MiB = 1u << 20;
constexpr size_t WS_CTL = 0, CTL_ZERO_BYTES = 1 * MiB;
constexpr size_t WS_WIN = 2 * MiB, WS_WBR = 58 * MiB, WS_WOUT = 66 * MiB, WS_WUP = 74 * MiB, WS_WDN = 334 * MiB;
constexpr size_t WS_XB = 464 * MiB, WS_SMALL = 496 * MiB, WS_EG = 497 * MiB, WS_BETA = WS_EG + 256 * 1024, WS_COMB = 498 * MiB;
constexpr size_t WS_Z = 500 * MiB, WS_GQ = 724 * MiB, WS_GK = 740 * MiB, WS_GV = 756 * MiB, WS_GO = 772 * MiB, WS_HO = 788 * MiB;
constexpr size_t WS_BR = 804 * MiB, WS_MTMP = 836 * MiB, WS_MSUM = 900 * MiB, WS_Y = 932 * MiB, WS_X1 = 996 * MiB, WS_X1B = 1060 * MiB;
constexpr size_t WS_XCUR = 1092 * MiB, WS_HB = 1156 * MiB, WS_YEXP = 1236 * MiB, WS_LIST = 1524 * MiB, WS_WL = 1526 * MiB, WS_SLOT = 1528 * MiB, WS_MQ = 1530 * MiB, WS_MS = 1534 * MiB, WS_MK = 1538 * MiB, WS_MV = 1542 * MiB, WS_MFL = 1552 * MiB, WS_HDEN = WS_MFL + 65536, WS_VT = 1553 * MiB, WS_END = 1561 * MiB;
constexpr size_t WS_GU = WS_GQ, WS_GNW = WS_GK, WS_GQG = WS_GK + 8 * MiB, WS_GKT = WS_GV, WS_GAT = WS_GV + 8 * MiB, WS_GDL = WS_GV + 12 * MiB;
constexpr int HROWS = 73728;
static_assert(WS_HB + (size_t)HROWS * ED * 2 <= WS_YEXP && WS_YEXP + (size_t)HROWS * D * 2 <= WS_LIST, "ws map (moe)");
static_assert(WS_WIN + (size_t)ZC * D * 2 <= WS_WBR && WS_WUP + (size_t)NEX * 1024 * D * 2 <= WS_WDN && WS_WDN + (size_t)D * HK * 2 <= WS_XB, "ws map (weights)");
static_assert(WS_Z + (size_t)T * ZC * 2 <= WS_GQ, "ws map (acts)");
constexpr int CW_BAR = 4096, CW_CNT = 16384;
constexpr int TAB_OFF = 131072 + 1024;
constexpr int LDS_BYTES = 163840, MISC_OFF = 131072 + 320;

__device__ __forceinline__ float bflo(unsigned w) { return __uint_as_float(w << 16); }
__device__ __forceinline__ float bfhi(unsigned w) { return __uint_as_float(w & 0xffff0000u); }
__device__ __forceinline__ unsigned f2bf(float f) { unsigned u = __float_as_uint(f); return (u + 0x7fffu + ((u >> 16) & 1u)) >> 16; }
__device__ __forceinline__ unsigned pk2(float lo, float hi) { return f2bf(lo) | (f2bf(hi) << 16); }
template <int CTRL> __device__ __forceinline__ float dpp(float x) { return __builtin_bit_cast(float, __builtin_amdgcn_mov_dpp(__builtin_bit_cast(int, x), CTRL, 0xf, 0xf, true)); }
__device__ __forceinline__ float sum4(float x) { x += dpp<0xB1>(x); x += dpp<0x4E>(x); return x; }
__device__ __forceinline__ float sum8(float x) { x = sum4(x); x += dpp<0x141>(x); return x; }
__device__ __forceinline__ float sum16(float x) { x = sum8(x); x += dpp<0x140>(x); return x; }
__device__ __forceinline__ float wave_sum(float x) { x = sum16(x); x += __shfl_xor(x, 16); x += __shfl_xor(x, 32); return x; }
__device__ __forceinline__ float max8(float x) { x = fmaxf(x, dpp<0xB1>(x)); x = fmaxf(x, dpp<0x4E>(x)); x = fmaxf(x, dpp<0x141>(x)); return x; }
__device__ __forceinline__ float min8(float x) { x = fminf(x, dpp<0xB1>(x)); x = fminf(x, dpp<0x4E>(x)); x = fminf(x, dpp<0x141>(x)); return x; }
__device__ __forceinline__ float wave_scan_incl(float v) {
    v += __builtin_bit_cast(float, __builtin_amdgcn_update_dpp(0, __builtin_bit_cast(int, v), 0x111, 0xf, 0xf, true));
    v += __builtin_bit_cast(float, __builtin_amdgcn_update_dpp(0, __builtin_bit_cast(int, v), 0x112, 0xf, 0xf, true));
    v += __builtin_bit_cast(float, __builtin_amdgcn_update_dpp(0, __builtin_bit_cast(int, v), 0x114, 0xf, 0xf, true));
    v += __builtin_bit_cast(float, __builtin_amdgcn_update_dpp(0, __builtin_bit_cast(int, v), 0x118, 0xf, 0xf, true));
    v += __builtin_bit_cast(float, __builtin_amdgcn_update_dpp(0, __builtin_bit_cast(int, v), 0x142, 0xa, 0xf, false));
    v += __builtin_bit_cast(float, __builtin_amdgcn_update_dpp(0, __builtin_bit_cast(int, v), 0x143, 0xc, 0xf, false));
    return v;
}
__device__ __forceinline__ float sigmoidf_(float x) { return 1.f / (1.f + __expf(-x)); }
__device__ __forceinline__ float siluf_(float x) { return x / (1.f + __expf(-x)); }
__device__ __forceinline__ float softplusf_(float x) { return fmaxf(x, 0.f) + __logf(1.f + __expf(-fabsf(x))); }
__device__ __forceinline__ float gelu_tanh(float x) { const float y = 0.7978845608f * (x + 0.044715f * x * x * x); const float t = 1.f - 2.f / (__expf(2.f * y) + 1.f); return 0.5f * x * (1.f + t); }
__device__ __forceinline__ void unpack8(const v4u r, float (&f)[8]) { f[0] = bflo(r.x); f[1] = bfhi(r.x); f[2] = bflo(r.y); f[3] = bfhi(r.y); f[4] = bflo(r.z); f[5] = bfhi(r.z); f[6] = bflo(r.w); f[7] = bfhi(r.w); }
#define XB_TMO      128
#define XB_XCNT(j)  (256  + 64 * (j))
#define XB_XSUB(j)  (1280 + 64 * (j))
#define XB_XGEN(j)  (2304 + 64 * (j))
#define XB_TOP      3328
#define XB_TOPGEN   3392
#define XCD_BAR_WORDS 3456
#define XB_SPIN_CAP (1u << 18)

__device__ __forceinline__ unsigned xb_ld(unsigned* p)              { return __hip_atomic_load(p, __ATOMIC_RELAXED, __HIP_MEMORY_SCOPE_AGENT); }
__device__ __forceinline__ unsigned xb_add(unsigned* p, unsigned v) { return __hip_atomic_fetch_add(p, v, __ATOMIC_RELAXED, __HIP_MEMORY_SCOPE_AGENT); }
__device__ __forceinline__ unsigned xb_xcc_id() { return (unsigned)__builtin_amdgcn_s_getreg((3 << 11) | 20) & 0xFu; }
#define XB_SPIN(cond, bar) do { unsigned _sp = 0; while (cond) { __builtin_amdgcn_s_sleep(1); \
    if ((++_sp & 255u) == 0u) { if (xb_ld(&(bar)[XB_TMO])) break; if (_sp > XB_SPIN_CAP) { atomicAdd(&(bar)[XB_TMO], 1u); break; } } } } while (0)

struct XcdBarrier {
    unsigned* bar; unsigned x;
    volatile LAS unsigned* st;
};

__device__ __forceinline__ XcdBarrier xcd_barrier_post(unsigned* bar, volatile LAS unsigned* st) {
    XcdBarrier b; b.bar = bar; b.x = xb_xcc_id(); b.st = st;
    if (threadIdx.x == 0) (void)xb_add(&bar[XB_XCNT(b.x)], 1u);
    return b;
}
__device__ __forceinline__ void xcd_barrier_complete(unsigned* bar, unsigned x, unsigned& nloc, unsigned& nx) {
    const unsigned G = gridDim.x * gridDim.y * gridDim.z;
    unsigned sum, cnt, mine, sp = 0u;
    for (;;) {
        sum = 0u; cnt = 0u; mine = 0u;
#pragma unroll
        for (unsigned j = 0; j < 16; ++j) { const unsigned c = xb_ld(&bar[XB_XCNT(j)]); sum += c; cnt += (c > 0u) ? 1u : 0u; mine = (j == x) ? c : mine; }
        if (sum == G) break;
        __builtin_amdgcn_s_sleep(1);
        if ((++sp & 255u) == 0u) { if (xb_ld(&bar[XB_TMO])) break; if (sp > XB_SPIN_CAP) { atomicAdd(&bar[XB_TMO], 1u); break; } }
    }
    nloc = mine > 0u ? mine : 1u; nx = cnt > 0u ? cnt : 1u;
}

__device__ __forceinline__ void xcd_barrier(const XcdBarrier& b) {
    asm volatile("s_waitcnt vmcnt(0)" ::: "memory");
    __syncthreads();
    if (threadIdx.x == 0) {
        unsigned* bar = b.bar;
        __builtin_amdgcn_s_waitcnt(0);
        unsigned nloc = b.st[0], nx = b.st[1];
        if (nloc == 0u) { xcd_barrier_complete(bar, b.x, nloc, nx); b.st[0] = nloc; b.st[1] = nx; }
        const unsigned old = xb_add(&bar[XB_XSUB(b.x)], 1u);
        const unsigned gen = old / nloc;
        if (old + 1u == (gen + 1u) * nloc) {
            __builtin_amdgcn_fence(__ATOMIC_RELEASE, "agent");
            asm volatile("s_waitcnt vmcnt(0)" ::: "memory");
            const unsigned og = xb_add(&bar[XB_TOP], 1u);
            const unsigned tg = og / nx;
            if (og + 1u == (tg + 1u) * nx) xb_add(&bar[XB_TOPGEN], 1u);
            else XB_SPIN(xb_ld(&bar[XB_TOPGEN]) == tg, bar);
            __builtin_amdgcn_fence(__ATOMIC_ACQUIRE, "agent");
            xb_add(&bar[XB_XGEN(b.x)], 1u);
            asm volatile("s_waitcnt vmcnt(0)" ::: "memory");
        } else {
            XB_SPIN(xb_ld(&bar[XB_XGEN(b.x)]) == gen, bar);
            __builtin_amdgcn_fence(__ATOMIC_ACQUIRE, "agent");
            asm volatile("s_waitcnt vmcnt(0)" ::: "memory");
        }
    }
    __syncthreads();
}

struct Params { const float* in[27]; float* out; unsigned char* ws; int ph_lo, ph_hi; };
enum { I_X = 0, I_WIN, I_GMNG, I_GMNB, I_GMWS, I_GMBS, I_CONVW, I_ALOG, I_DTB, I_GDNNG, I_MLIB, I_MLFB, I_MLNG, I_WBR, I_WOUT, I_LN1G, I_LN1B,
       I_WR, I_RB, I_WG, I_WU, I_WD, I_SG, I_SU, I_SD, I_LN2G, I_LN2B };

using pg8::f32x4; using pg8::u32x4; using pg8::Unit; using pg8::HALF; using pg8::BM;

struct MergeOrder {
    int G, c;
    __device__ bool next(int i, Unit& u) const {
        const long L = (long)(i >> 2) * G + c; if (L >= 256) return false;
        const int g = i & 3; int wgid = (int)L; { const int q = 256 / 8, xcd = wgid % 8, off = wgid / 8; wgid = xcd * q + off; }
        const int nN = 8, nig = 8 * nN, gid = wgid / nig, fm = gid * 8; const int pm = fm + ((wgid % nig) % 8), pn = (wgid % nig) / 8;
        u.pm = g * 32 + pm; u.pn = g * 8 + pn; return true;
    }
    __device__ __forceinline__ void a_ready(const Unit&) const {}
    __device__ __forceinline__ void done(const Unit&) const {}
};
struct EpiMerge {
    static constexpr bool PERM = true, AFTER_DRAIN = false;
    const bf16* Z; float* tmp; bf16* msum;
    __device__ __forceinline__ void operator()(const f32x4 (&acc)[2][2][4][2], const Unit& u, int wr, int wc, int fr, int fq) const {
        const int g = u.pm >> 5, pm = u.pm & 31, pn = u.pn & 7;
        const int row0 = pm * BM + wr * 64 + fr, col0 = pn * BM + wc * 32 + 8 * fq;
#pragma unroll
        for (int ai = 0; ai < 2; ++ai)
#pragma unroll
            for (int m = 0; m < 4; ++m) { const size_t row = (size_t)(row0 + ai * HALF + m * 16);
#pragma unroll
                for (int bj = 0; bj < 2; ++bj) { const int col = col0 + bj * HALF;
                    const v4u gr = *(const v4u*)(Z + row * ZC + ZC_GATE + g * D + col); float gl[8]; unpack8(gr, gl);
                    float* tp = tmp + row * D + col; f32x4 v0 = acc[ai][bj][m][0], v1 = acc[ai][bj][m][1];
#pragma unroll
                    for (int j = 0; j < 4; ++j) { v0[j] *= sigmoidf_(gl[j]); v1[j] *= sigmoidf_(gl[4 + j]); }
                    if (g > 0) { v0 += *(const f32x4*)tp; v1 += *(const f32x4*)(tp + 4); }
                    if (g < 3) { *(f32x4*)tp = v0; *(f32x4*)(tp + 4) = v1; }
                    else { u32x4 w; w.x = pk2(v0[0], v0[1]); w.y = pk2(v0[2], v0[3]); w.z = pk2(v1[0], v1[1]); w.w = pk2(v1[2], v1[3]); *(u32x4*)(msum + row * D + col) = w; } }
                asm volatile("" ::: "memory"); }
    }
};
struct EpiResid {
    static constexpr bool PERM = false, AFTER_DRAIN = false;
    const float* X; float* Y;
    __device__ __forceinline__ void operator()(const f32x4 (&acc)[2][2][4][2], const Unit& u, int wr, int wc, int fr, int fq) const {
        const int row0 = u.pm * BM + wr * 64 + fr, col0 = u.pn * BM + wc * 32 + 4 * fq;
#pragma unroll
        for (int ai = 0; ai < 2; ++ai)
#pragma unroll
            for (int m = 0; m < 4; ++m) { const size_t off = (size_t)(row0 + ai * HALF + m * 16) * D + col0;
#pragma unroll
                for (int bj = 0; bj < 2; ++bj)
#pragma unroll
                    for (int n = 0; n < 2; ++n) { const f32x4 xv = *(const f32x4*)(X + off + bj * HALF + n * 16); *(f32x4*)(Y + off + bj * HALF + n * 16) = xv * ALPHA + acc[ai][bj][m][n]; } }
    }
};
struct MoeTab {
    LAS int* t; LAS unsigned short* tok; LAS float* wt; LAS unsigned char* mte;
    __device__ __forceinline__ MoeTab(LAS unsigned char* lds) : t((LAS int*)(lds + TAB_OFF)), tok((LAS unsigned short*)(lds + TAB_OFF + 1024)), wt((LAS float*)(lds + TAB_OFF + 5120)), mte((LAS unsigned char*)(lds + TAB_OFF + 13312)) {}
};
__device__ __forceinline__ void moe_tables(const MoeTab& M, const unsigned* cnt  , int tid, int lane, int wave) {
    __syncthreads();
    if (wave == 0) { const int c = (int)cnt[64 * lane]; const int tiles = (c + 255) >> 8; const float incl = wave_scan_incl((float)tiles);
        M.t[80 + lane] = c; M.t[lane] = (int)incl - tiles; if (lane == 63) { M.t[64] = (int)incl; M.t[65] = (int)incl + T / 256; M.t[80 + 64] = T; } }
    __syncthreads();
    const int Mt = M.t[65];
    for (int mt = tid; mt < Mt; mt += 512) { int e = 0;
        for (int k = 1; k <= 64; ++k) e = (M.t[k] <= mt) ? k : e;
        M.mte[mt] = (unsigned char)e; }
    __syncthreads();
}
struct UpOrder {
    MoeTab M; int n;
    __device__ __forceinline__ bool next(int i, Unit& u) const { if (i >= n) return false; u.pm = M.t[168 + i]; u.pn = M.t[176 + i]; u.aux = i; return true; }
    __device__ __forceinline__ int row_token(int i, int r) const { return (int)M.tok[i * 256 + r]; }
    __device__ __forceinline__ void a_ready(const Unit&) const {}
    __device__ __forceinline__ void done(const Unit&) const {}
};
__device__ __forceinline__ int up_order_build(const MoeTab& M, const int* LIST, const float* WL, int wg, int G, int tid) {
    const int U = 4 * M.t[65];
    if (tid < 8) { const int L = tid * G + wg; if (L < U) { const int mt = L >> 2, q = L & 3, e = M.mte[mt]; M.t[168 + tid] = mt; M.t[176 + tid] = e * 4 + q; M.t[184 + tid] = e; M.t[192 + tid] = mt - M.t[e]; } }
    int n = 0;
#pragma unroll
    for (int i = 0; i < 8; ++i) n += (i * G + wg < U) ? 1 : 0;
    __syncthreads();
    for (int idx = tid; idx < n * 256; idx += 512) { const int i = idx >> 8, r = idx & 255, e = M.t[184 + i], li = M.t[192 + i] * 256 + r;
        int tk = 0; float w = 0.f;
        if (e < NE) { if (li < M.t[80 + e]) { tk = LIST[e * T + li]; w = WL[e * T + li]; } } else { tk = li; w = 1.f; }
        M.tok[idx] = (unsigned short)tk; M.wt[idx] = w; }
    __syncthreads();
    return n;
}
struct EpiGluSparse {
    static constexpr bool PERM = true, AFTER_DRAIN = false;
    LAS const float* wt; bf16* H;
    __device__ __forceinline__ void operator()(const f32x4 (&acc)[2][2][4][2], const Unit& u, int wr, int wc, int fr, int fq) const {
        const int q = u.pn & 3; const int rl0 = wr * 64 + fr, col0 = q * 128 + wc * 32 + 8 * fq;
#pragma unroll
        for (int ai = 0; ai < 2; ++ai)
#pragma unroll
            for (int m = 0; m < 4; ++m) { const int rl = rl0 + ai * HALF + m * 16; const float c = wt[u.aux * 256 + rl]; float h[8];
#pragma unroll
                for (int n = 0; n < 2; ++n)
#pragma unroll
                    for (int j = 0; j < 4; ++j) h[4 * n + j] = siluf_(acc[ai][0][m][n][j]) * acc[ai][1][m][n][j] * c;
                u32x4 w; w.x = pk2(h[0], h[1]); w.y = pk2(h[2], h[3]); w.z = pk2(h[4], h[5]); w.w = pk2(h[6], h[7]);
                *(u32x4*)(H + ((size_t)u.pm * 256 + rl) * ED + col0) = w; }
    }
};
struct DownOrder {
    MoeTab M; int G, c, U;
    __device__ __forceinline__ bool next(int i, Unit& u) const { const int L = i * G + c; if (L >= U) return false; const int mt = L >> 3; u.pm = mt; u.pn = (int)M.mte[mt] * 8 + (L & 7); u.aux = 0; return true; }
    __device__ __forceinline__ void a_ready(const Unit&) const {}
    __device__ __forceinline__ void done(const Unit&) const {}
};
struct EpiYexp {
    static constexpr bool PERM = true, AFTER_DRAIN = false;
    bf16* Y;
    __device__ __forceinline__ void operator()(const f32x4 (&acc)[2][2][4][2], const Unit& u, int wr, int wc, int fr, int fq) const {
        const int row0 = u.pm * BM + wr * 64 + fr, col0 = (u.pn & 7) * BM + wc * 32 + 8 * fq;
#pragma unroll
        for (int ai = 0; ai < 2; ++ai)
#pragma unroll
            for (int m = 0; m < 4; ++m) { bf16* rowp = Y + (size_t)(row0 + ai * HALF + m * 16) * D + col0;
#pragma unroll
                for (int bj = 0; bj < 2; ++bj) { const f32x4 v0 = acc[ai][bj][m][0], v1 = acc[ai][bj][m][1];
                    u32x4 w; w.x = pk2(v0[0], v0[1]); w.y = pk2(v0[2], v0[3]); w.z = pk2(v1[0], v1[1]); w.w = pk2(v1[2], v1[3]); *(u32x4*)(rowp + bj * HALF) = w; } }
    }
};

__device__ __forceinline__ void tr_item(const float* src, size_t sld, bf16* dst, size_t dld, LAS float* scr, int lane) {
#pragma unroll 8
    for (int i = 0; i < 32; ++i) { const int kk = 2 * i + (lane >> 5); scr[kk * 33 + (lane & 31)] = src[(size_t)kk * sld + (lane & 31)]; }
    LDS_WAIT(); asm volatile("" ::: "memory");
    const int c = lane & 7;
#pragma unroll
    for (int j = 0; j < 4; ++j) { const int n = (lane >> 3) + 8 * j; const LAS float* s = scr + (8 * c) * 33 + n;
        v4u o; o.x = pk2(s[0 * 33], s[1 * 33]); o.y = pk2(s[2 * 33], s[3 * 33]); o.z = pk2(s[4 * 33], s[5 * 33]); o.w = pk2(s[6 * 33], s[7 * 33]);
        *(v4u*)(dst + (size_t)n * dld + 8 * c) = o; }
    LDS_WAIT(); asm volatile("" ::: "memory");
}
__device__ __forceinline__ void phase_convert(const Params& p, int l, LAS unsigned char* lds, int gw, int NGW, int wave, int lane) {
    unsigned char* ws = p.ws;
    const float* w_in = p.in[I_WIN] + (size_t)l * D * INC; const float* w_br = p.in[I_WBR] + (size_t)l * 4 * BW * D; const float* w_out = p.in[I_WOUT] + (size_t)l * D * D;
    const float* w_g = p.in[I_WG] + (size_t)l * NE * D * ED; const float* w_u = p.in[I_WU] + (size_t)l * NE * D * ED; const float* w_d = p.in[I_WD] + (size_t)l * NE * ED * D;
    const float* s_g = p.in[I_SG] + (size_t)l * D * ED; const float* s_u = p.in[I_SU] + (size_t)l * D * ED; const float* s_d = p.in[I_SD] + (size_t)l * ED * D;
    bf16* WIN = (bf16*)(ws + WS_WIN); bf16* WBR = (bf16*)(ws + WS_WBR); bf16* WOUT = (bf16*)(ws + WS_WOUT); bf16* WUP = (bf16*)(ws + WS_WUP); bf16* WDN = (bf16*)(ws + WS_WDN);
    LAS float* scr = (LAS float*)(lds + wave * 16384);
    constexpr int N_IN = (ZC / 32) * (D / 64), N_BR = 4 * (BW / 64) * (D / 32), N_OUT = (D / 64) * (D / 32), N_UP = NEX * 2 * (D / 64) * (ED / 32), N_DN = NEX * (ED / 64) * (D / 32);
    constexpr int NITEMS = N_IN + N_BR + N_OUT + N_UP + N_DN;
    for (int it = gw; it < NITEMS; it += NGW) {
        int r = it;
        if (r < N_IN) { const int kb = r / (ZC / 32), n0 = (r % (ZC / 32)) * 32, k0 = kb * 64; const int sc = n0 + (n0 >= ZC_GATE ? 16 : (n0 >= ZC_MLQ ? 8 : 0));
            tr_item(w_in + (size_t)k0 * INC + sc, INC, WIN + (size_t)n0 * D + k0, D, scr, lane); continue; } r -= N_IN;
        if (r < N_BR) { const int g = r / 512, rr = r % 512, k0 = (rr / 64) * 64, n0 = (rr % 64) * 32;
            tr_item(w_br + ((size_t)g * BW + k0) * D + n0, D, WBR + ((size_t)g * D + n0) * BW + k0, BW, scr, lane); continue; } r -= N_BR;
        if (r < N_OUT) { const int k0 = (r / 64) * 64, n0 = (r % 64) * 32;
            tr_item(w_out + (size_t)k0 * D + n0, D, WOUT + (size_t)n0 * D + k0, D, scr, lane); continue; } r -= N_OUT;
        if (r < N_UP) { const int e = r / 1024, rr = r % 1024, mat = rr / 512, r2 = rr % 512, k0 = (r2 / 16) * 64, n0 = (r2 % 16) * 32;
            const float* sb = (e < NE) ? ((mat ? w_u : w_g) + (size_t)e * D * ED) : (mat ? s_u : s_g);
            const int drow = e * 1024 + (n0 / 128) * 256 + mat * 128 + (n0 % 128);
            tr_item(sb + (size_t)k0 * ED + n0, ED, WUP + (size_t)drow * D + k0, D, scr, lane); continue; } r -= N_UP;
        { const int e = r / 512, rr = r % 512, k0 = (rr / 64) * 64, n0 = (rr % 64) * 32;
            const float* sb = (e < NE) ? (w_d + (size_t)e * ED * D) : s_d;
            tr_item(sb + (size_t)k0 * D + n0, D, WDN + ((size_t)e * D + n0) * ED + k0, ED, scr, lane); }
    }
}
__device__ __forceinline__ void phase_xprep(const Params& p, int l, const float* xin, LAS unsigned char* lds, int gw, int NGW, int tid, int lane) {
    const float* w_in = p.in[I_WIN] + (size_t)l * D * INC; LAS float* wsm = (LAS float*)lds;
    __syncthreads();
    for (int idx = tid; idx < D * 16; idx += 512) { const int d = idx >> 4, c = idx & 15; wsm[c * D + d] = w_in[(size_t)d * INC + (c < 8 ? 4608 + c : 6152 + (c - 8))]; }
    __syncthreads();
    bf16* XB = (bf16*)(p.ws + WS_XB); float* SMALL = (float*)(p.ws + WS_SMALL);
    for (int m = gw; m < T; m += NGW) {
        const v4f* xr = (const v4f*)(xin + (size_t)m * D) + lane; v4f v[8];
#pragma unroll
        for (int j = 0; j < 8; ++j) v[j] = xr[64 * j];
        v2u* xo = (v2u*)(XB + (size_t)m * D) + lane;
#pragma unroll
        for (int j = 0; j < 8; ++j) { v2u o; o.x = pk2(v[j].x, v[j].y); o.y = pk2(v[j].z, v[j].w); xo[64 * j] = o; }
        float res = 0.f;
#pragma unroll 1
        for (int c = 0; c < 16; ++c) { float a = 0.f;
#pragma unroll
            for (int j = 0; j < 8; ++j) { const v4f w = *(const LAS v4f*)(wsm + c * D + 4 * lane + 256 * j); a += v[j].x * w.x + v[j].y * w.y + v[j].z * w.z + v[j].w * w.w; }
            a = wave_sum(a); if (lane == c) res = a; }
        if (lane < 16) SMALL[(size_t)m * 16 + lane] = res;
    }
    __syncthreads();
}


typedef short bf16x8_t __attribute__((ext_vector_type(8)));
__device__ __forceinline__ void ml_pre_item(const Params& p, int l, LAS unsigned char* lds, int item, int tid, int wave, int lane) {
    const int h = item & 3, n = item >> 2; const size_t t0 = (size_t)n * 64;
    const bf16* Z = (const bf16*)(p.ws + WS_Z); const float* SMALL = (const float*)(p.ws + WS_SMALL);
    bf16* MQ = (bf16*)(p.ws + WS_MQ) + (size_t)item * 4096; bf16* MS = (bf16*)(p.ws + WS_MS) + (size_t)item * 4096; bf16* MK = (bf16*)(p.ws + WS_MK) + (size_t)item * 4096;
    bf16* MV = (bf16*)(p.ws + WS_MV) + (size_t)item * 9216; float* MFL = (float*)(p.ws + WS_MFL);
    LAS float* qs = (LAS float*)lds;
    LAS float* ks = qs + 64 * 65;
    LAS float* bs = ks + 64 * 65;
    LAS unsigned short* vs = (LAS unsigned short*)(bs + 128);
    { const int tk = tid >> 3, c8 = tid & 7; float f[8];
      unpack8(*(const v4u*)(Z + (t0 + tk) * ZC + ZC_MLQ + h * 64 + 8 * c8), f);
#pragma unroll
      for (int i = 0; i < 8; ++i) qs[tk * 65 + 8 * c8 + i] = f[i];
      unpack8(*(const v4u*)(Z + (t0 + tk) * ZC + ZC_MLK + h * 64 + 8 * c8), f);
#pragma unroll
      for (int i = 0; i < 8; ++i) ks[tk * 65 + 8 * c8 + i] = f[i]; }
#pragma unroll
    for (int r = 0; r < 2; ++r) { const int idx = tid + 512 * r, tk = idx >> 4, c8 = idx & 15;
        *(LAS v4u*)(vs + tk * 136 + 8 * c8) = *(const v4u*)(Z + (t0 + tk) * ZC + ZC_MLV + h * 128 + 8 * c8); }
    if (wave == 0) { const float fp = SMALL[(t0 + lane) * 16 + 12 + h] + p.in[I_MLFB][l * 4 + h]; const float lf = -softplusf_(-fp);
        bs[lane] = wave_scan_incl(lf); bs[64 + lane] = SMALL[(t0 + lane) * 16 + 8 + h] + p.in[I_MLIB][l * 4 + h]; }
    __syncthreads();
    const float blast = bs[63];
    { const int i = tid >> 3, jb = tid & 7; const float bi = bs[i];
      { const float e = __expf(bi) * 0.125f; float o[8];
#pragma unroll
        for (int x = 0; x < 8; ++x) o[x] = qs[i * 65 + 8 * jb + x] * e;
        v4u w; w.x = pk2(o[0], o[1]); w.y = pk2(o[2], o[3]); w.z = pk2(o[4], o[5]); w.w = pk2(o[6], o[7]); *(v4u*)(MQ + i * 64 + 8 * jb) = w; }
      { float d[8];
#pragma unroll
        for (int x = 0; x < 8; ++x) d[x] = 0.f;
        if (8 * jb <= i) {
            for (int dd = 0; dd < 64; ++dd) { const float qv = qs[i * 65 + dd];
#pragma unroll
                for (int x = 0; x < 8; ++x) d[x] += qv * ks[(8 * jb + x) * 65 + dd]; }
#pragma unroll
            for (int x = 0; x < 8; ++x) { const int j = 8 * jb + x; d[x] = (j <= i) ? __expf(bi - bs[j] + bs[64 + j]) * d[x] * 0.125f : 0.f; } }
        v4u w; w.x = pk2(d[0], d[1]); w.y = pk2(d[2], d[3]); w.z = pk2(d[4], d[5]); w.w = pk2(d[6], d[7]); *(v4u*)(MS + i * 64 + 8 * jb) = w; }
      { float o[8];
#pragma unroll
        for (int x = 0; x < 8; ++x) { const int j = 8 * jb + x; o[x] = ks[j * 65 + i] * __expf(blast - bs[j] + bs[64 + j]); }
        v4u w; w.x = pk2(o[0], o[1]); w.y = pk2(o[2], o[3]); w.z = pk2(o[4], o[5]); w.w = pk2(o[6], o[7]); *(v4u*)(MK + i * 64 + 8 * jb) = w; }
    }
    { const int c = tid >> 2, jq = tid & 3; unsigned w[8];
#pragma unroll
      for (int x = 0; x < 8; ++x) w[x] = (unsigned)vs[(16 * jq + 2 * x) * 136 + c] | ((unsigned)vs[(16 * jq + 2 * x + 1) * 136 + c] << 16);
      *(v4u*)(MV + c * 64 + 16 * jq) = (v4u){w[0], w[1], w[2], w[3]}; *(v4u*)(MV + c * 64 + 16 * jq + 8) = (v4u){w[4], w[5], w[6], w[7]};
      if (tid < 64) { const int c2 = 128 + (tid >> 2); const unsigned one = (c2 == 128) ? 0x3F803F80u : 0u;
          *(v4u*)(MV + c2 * 64 + 16 * jq) = (v4u){one, one, one, one}; *(v4u*)(MV + c2 * 64 + 16 * jq + 8) = (v4u){one, one, one, one}; } }
    if (tid == 0) MFL[item] = __expf(blast);
    __syncthreads();
}
struct MlFrags { bf16x8_t q[2], s[2], kt[2], vt[2]; float fl; };
__device__ __forceinline__ void ml_load(MlFrags& F, const Params& p, int item, int offA, int offV) {
    const bf16* MQ = (const bf16*)(p.ws + WS_MQ) + (size_t)item * 4096; const bf16* MS = (const bf16*)(p.ws + WS_MS) + (size_t)item * 4096; const bf16* MK = (const bf16*)(p.ws + WS_MK) + (size_t)item * 4096;
    const bf16* MV = (const bf16*)(p.ws + WS_MV) + (size_t)item * 9216;
#pragma unroll
    for (int ks = 0; ks < 2; ++ks) { F.q[ks] = *(const bf16x8_t*)(MQ + offA + 32 * ks); F.s[ks] = *(const bf16x8_t*)(MS + offA + 32 * ks); F.kt[ks] = *(const bf16x8_t*)(MK + offA + 32 * ks); F.vt[ks] = *(const bf16x8_t*)(MV + offV + 32 * ks); }
    F.fl = ((const float*)(p.ws + WS_MFL))[item];
}
__device__ __forceinline__ void ml_seq(const Params& p, LAS unsigned char* lds, int wgi, int wave, int lane) {
    const int u = wgi * 2 + (wave >> 2), wi = wave & 3, h = u / 9, sl = u % 9, g = lane >> 4, c = lane & 15;
    LAS unsigned short* CT = (LAS unsigned short*)(lds + (wave >> 2) * 4096);
    float* HO = (float*)(p.ws + WS_HO); float* HDEN = (float*)(p.ws + WS_HDEN);
    const int offA = (16 * wi + c) * 64 + 8 * g, offV = (16 * sl + c) * 64 + 8 * g;
    *(LAS v2u*)(CT + c * 64 + 16 * wi + 4 * g) = (v2u){0u, 0u};
    pg8::f32x4 Cacc = {0.f, 0.f, 0.f, 0.f};
    __syncthreads();
    MlFrags F0, F1;
    ml_load(F0, p, h, offA, offV);
#define ML_STEP(F, n_) do { const int cur = (n_) & 1; \
        const bf16x8_t c0 = *(const LAS bf16x8_t*)(CT + cur * 1024 + c * 64 + 8 * g), c1 = *(const LAS bf16x8_t*)(CT + cur * 1024 + c * 64 + 32 + 8 * g); \
        pg8::f32x4 num = {0.f, 0.f, 0.f, 0.f}; \
        num = __builtin_amdgcn_mfma_f32_16x16x32_bf16(F.q[0], c0, num, 0, 0, 0); num = __builtin_amdgcn_mfma_f32_16x16x32_bf16(F.q[1], c1, num, 0, 0, 0); \
        num = __builtin_amdgcn_mfma_f32_16x16x32_bf16(F.s[0], F.vt[0], num, 0, 0, 0); num = __builtin_amdgcn_mfma_f32_16x16x32_bf16(F.s[1], F.vt[1], num, 0, 0, 0); \
        Cacc = Cacc * F.fl; \
        Cacc = __builtin_amdgcn_mfma_f32_16x16x32_bf16(F.kt[0], F.vt[0], Cacc, 0, 0, 0); Cacc = __builtin_amdgcn_mfma_f32_16x16x32_bf16(F.kt[1], F.vt[1], Cacc, 0, 0, 0); \
        { v2u w; w.x = pk2(Cacc[0], Cacc[1]); w.y = pk2(Cacc[2], Cacc[3]); *(LAS v2u*)(CT + (cur ^ 1) * 1024 + c * 64 + 16 * wi + 4 * g) = w; } \
        { const size_t tb = (size_t)(n_) * 64 + 16 * wi + 4 * g; \
          if (sl < 8) { _Pragma("unroll") for (int r = 0; r < 4; ++r) HO[(tb + r) * BW + h * 128 + 16 * sl + c] = num[r]; } \
          else if (c == 0) { _Pragma("unroll") for (int r = 0; r < 4; ++r) HDEN[(tb + r) * 4 + h] = num[r]; } } \
        LDS_BAR(); } while (0)
    for (int n = 0; n < T / 64; n += 2) {
        ml_load(F1, p, (n + 1) * 4 + h, offA, offV);
        ML_STEP(F0, n);
        ml_load(F0, p, ((n + 2 < T / 64) ? n + 2 : n) * 4 + h, offA, offV);
        ML_STEP(F1, n + 1);
    }
#undef ML_STEP
}


constexpr int QP = 132;
__device__ __forceinline__ void gdn_pre_item(const Params& p, int l, LAS unsigned char* lds, int item, int tid, int wave, int lane) {
    const int h = item & 3, n = item >> 2; const size_t t0 = (size_t)n * 64;
    const bf16* Z = (const bf16*)(p.ws + WS_Z); const float* SMALL = (const float*)(p.ws + WS_SMALL);
    float* GU = (float*)(p.ws + WS_GU) + (size_t)item * 8192; bf16* GNW = (bf16*)(p.ws + WS_GNW) + (size_t)item * 8192; bf16* GQG = (bf16*)(p.ws + WS_GQG) + (size_t)item * 8192;
    bf16* GAT = (bf16*)(p.ws + WS_GAT) + (size_t)item * 4096; bf16* GKT = (bf16*)(p.ws + WS_GKT) + (size_t)item * 8192; float* GDL = (float*)(p.ws + WS_GDL);
    const float* cw = p.in[I_CONVW] + (size_t)l * 4 * 1536;
    LAS float* qs = (LAS float*)lds; LAS float* ks = qs + 64 * QP; LAS float* vs = ks + 64 * QP; LAS float* Ls = vs + 64 * QP;   LAS float* gcs = Ls + 64 * 68; LAS float* bts = gcs + 64; LAS float* btg = bts + 64;
    { const int tk = tid >> 3, part = tid & 7;
#pragma unroll 1
      for (int i = 0; i < 3; ++i) { float a[16];
#pragma unroll
        for (int x = 0; x < 16; ++x) a[x] = 0.f;
#pragma unroll
        for (int j = 0; j < 4; ++j) { const long tt = (long)t0 + tk - 3 + j; if (tt >= 0) {
            const bf16* src = Z + (size_t)tt * ZC + ZC_GDN + i * 512 + h * 128 + 16 * part; float x0[8], x1[8]; unpack8(*(const v4u*)src, x0); unpack8(*(const v4u*)(src + 8), x1);
            const float* wp = cw + j * 1536 + i * 512 + h * 128 + 16 * part;
#pragma unroll
            for (int x = 0; x < 8; ++x) { a[x] += wp[x] * x0[x]; a[8 + x] += wp[8 + x] * x1[x]; } } }
        float ss = 0.f;
#pragma unroll
        for (int x = 0; x < 16; ++x) { a[x] = siluf_(a[x]); ss += a[x] * a[x]; }
        if (i < 2) { ss = sum8(ss); const float r = rsqrtf(ss + 1e-6f) * (i == 0 ? 0.08838834764831845f : 1.f);
#pragma unroll
            for (int x = 0; x < 16; ++x) a[x] *= r; }
        LAS float* dst = (i == 0 ? qs : (i == 1 ? ks : vs)) + tk * QP + 16 * part;
#pragma unroll
        for (int x4 = 0; x4 < 4; ++x4) *(LAS v4f*)(dst + 4 * x4) = (v4f){a[4 * x4], a[4 * x4 + 1], a[4 * x4 + 2], a[4 * x4 + 3]}; } }
    if (wave == 0) { const float bb = SMALL[(t0 + lane) * 16 + h], aa = SMALL[(t0 + lane) * 16 + 4 + h];
        const float g = -__expf(p.in[I_ALOG][l * 4 + h]) * softplusf_(aa + p.in[I_DTB][l * 4 + h]);
        const float gc = wave_scan_incl(g), bt = sigmoidf_(bb); gcs[lane] = gc; bts[lane] = bt; btg[lane] = bt * __expf(gc); }
    __syncthreads();
    { const int i = tid >> 3, jb = tid & 7; const float gi = gcs[i], bi = bts[i]; float dk[8], dq[8];
#pragma unroll
      for (int x = 0; x < 8; ++x) { dk[x] = 0.f; dq[x] = 0.f; }
      if (8 * jb <= i) {
#pragma unroll 2
          for (int d4 = 0; d4 < 32; ++d4) { const v4f qi = *(const LAS v4f*)(qs + i * QP + 4 * d4), ki = *(const LAS v4f*)(ks + i * QP + 4 * d4);
#pragma unroll
              for (int x = 0; x < 8; ++x) { const v4f kj = *(const LAS v4f*)(ks + (8 * jb + x) * QP + 4 * d4);
                  dk[x] += ki.x * kj.x + ki.y * kj.y + ki.z * kj.z + ki.w * kj.w; dq[x] += qi.x * kj.x + qi.y * kj.y + qi.z * kj.z + qi.w * kj.w; } }
#pragma unroll
          for (int x = 0; x < 8; ++x) { const int j = 8 * jb + x; const float dc = __expf(gi - gcs[j]); dk[x] = (j < i) ? bi * dk[x] * dc : 0.f; dq[x] = (j <= i) ? dq[x] * dc : 0.f; } }
      *(LAS v4f*)(Ls + i * 68 + 8 * jb) = (v4f){dk[0], dk[1], dk[2], dk[3]}; *(LAS v4f*)(Ls + i * 68 + 8 * jb + 4) = (v4f){dk[4], dk[5], dk[6], dk[7]};
      v4u w; w.x = pk2(dq[0], dq[1]); w.y = pk2(dq[2], dq[3]); w.z = pk2(dq[4], dq[5]); w.w = pk2(dq[6], dq[7]); *(v4u*)(GAT + i * 64 + 8 * jb) = w; }
    __syncthreads();
    if (tid < 256) {
        const int c = tid; int vz; asm volatile("v_mov_b32 %0, 0" : "=v"(vz));
        const LAS float* rp = (c < 128) ? (vs + c) : (ks + (c - 128)); const LAS float* mp = ((c < 128) ? bts : btg) + vz;
#define GDN_RHS(i) (rp[(i) * QP] * mp[(i)])
#define GDN_L4(i, j4) (*(const LAS v4f*)(Ls + (i) * 68 + 4 * (j4) + vz))
        float x0 = GDN_RHS(0); __builtin_amdgcn_sched_barrier(0);
        float x1 = GDN_RHS(1); { const v4f l = GDN_L4(1, 0); x1 -= l.x * x0; } __builtin_amdgcn_sched_barrier(0);
        float x2 = GDN_RHS(2); { const v4f l = GDN_L4(2, 0); x2 -= l.x * x0; x2 -= l.y * x1; } __builtin_amdgcn_sched_barrier(0);
        float x3 = GDN_RHS(3); { const v4f l = GDN_L4(3, 0); x3 -= l.x * x0; x3 -= l.y * x1; x3 -= l.z * x2; } __builtin_amdgcn_sched_barrier(0);
        float x4 = GDN_RHS(4); { const v4f l = GDN_L4(4, 0); x4 -= l.x * x0; x4 -= l.y * x1; x4 -= l.z * x2; x4 -= l.w * x3; } __builtin_amdgcn_sched_barrier(0);
        float x5 = GDN_RHS(5); { const v4f l = GDN_L4(5, 0); x5 -= l.x * x0; x5 -= l.y * x1; x5 -= l.z * x2; x5 -= l.w * x3; } { const v4f l = GDN_L4(5, 1); x5 -= l.x * x4; } __builtin_amdgcn_sched_barrier(0);
        float x6 = GDN_RHS(6); { const v4f l = GDN_L4(6, 0); x6 -= l.x * x0; x6 -= l.y * x1; x6 -= l.z * x2; x6 -= l.w * x3; } { const v4f l = GDN_L4(6, 1); x6 -= l.x * x4; x6 -= l.y * x5; } __builtin_amdgcn_sched_barrier(0);
        float x7 = GDN_RHS(7); { const v4f l = GDN_L4(7, 0); x7 -= l.x * x0; x7 -= l.y * x1; x7 -= l.z * x2; x7 -= l.w * x3; } { const v4f l = GDN_L4(7, 1); x7 -= l.x * x4; x7 -= l.y * x5; x7 -= l.z * x6; } __builtin_amdgcn_sched_barrier(0);
        float x8 = GDN_RHS(8); { const v4f l = GDN_L4(8, 0); x8 -= l.x * x0; x8 -= l.y * x1; x8 -= l.z * x2; x8 -= l.w * x3; } { const v4f l = GDN_L4(8, 1); x8 -= l.x * x4; x8 -= l.y * x5; x8 -= l.z * x6; x8 -= l.w * x7; } __builtin_amdgcn_sched_barrier(0);
        float x9 = GDN_RHS(9); { const v4f l = GDN_L4(9, 0); x9 -= l.x * x0; x9 -= l.y * x1; x9 -= l.z * x2; x9 -= l.w * x3; } { const v4f l = GDN_L4(9, 1); x9 -= l.x * x4; x9 -= l.y * x5; x9 -= l.z * x6; x9 -= l.w * x7; } { const v4f l = GDN_L4(9, 2); x9 -= l.x * x8; } __builtin_amdgcn_sched_barrier(0);
        float x10 = GDN_RHS(10); { const v4f l = GDN_L4(10, 0); x10 -= l.x * x0; x10 -= l.y * x1; x10 -= l.z * x2; x10 -= l.w * x3; } { const v4f l = GDN_L4(10, 1); x10 -= l.x * x4; x10 -= l.y * x5; x10 -= l.z * x6; x10 -= l.w * x7; } { const v4f l = GDN_L4(10, 2); x10 -= l.x * x8; x10 -= l.y * x9; } __builtin_amdgcn_sched_barrier(0);
        float x11 = GDN_RHS(11); { const v4f l = GDN_L4(11, 0); x11 -= l.x * x0; x11 -= l.y * x1; x11 -= l.z * x2; x11 -= l.w * x3; } { const v4f l = GDN_L4(11, 1); x11 -= l.x * x4; x11 -= l.y * x5; x11 -= l.z * x6; x11 -= l.w * x7; } { const v4f l = GDN_L4(11, 2); x11 -= l.x * x8; x11 -= l.y * x9; x11 -= l.z * x10; } __builtin_amdgcn_sched_barrier(0);
        float x12 = GDN_RHS(12); { const v4f l = GDN_L4(12, 0); x12 -= l.x * x0; x12 -= l.y * x1; x12 -= l.z * x2; x12 -= l.w * x3; } { const v4f l = GDN_L4(12, 1); x12 -= l.x * x4; x12 -= l.y * x5; x12 -= l.z * x6; x12 -= l.w * x7; } { const v4f l = GDN_L4(12, 2); x12 -= l.x * x8; x12 -= l.y * x9; x12 -= l.z * x10; x12 -= l.w * x11; } __builtin_amdgcn_sched_barrier(0);
        float x13 = GDN_RHS(13); { const v4f l = GDN_L4(13, 0); x13 -= l.x * x0; x13 -= l.y * x1; x13 -= l.z * x2; x13 -= l.w * x3; } { const v4f l = GDN_L4(13, 1); x13 -= l.x * x4; x13 -= l.y * x5; x13 -= l.z * x6; x13 -= l.w * x7; } { const v4f l = GDN_L4(13, 2); x13 -= l.x * x8; x13 -= l.y * x9; x13 -= l.z * x10; x13 -= l.w * x11; } { const v4f l = GDN_L4(13, 3); x13 -= l.x * x12; } __builtin_amdgcn_sched_barrier(0);
        float x14 = GDN_RHS(14); { const v4f l = GDN_L4(14, 0); x14 -= l.x * x0; x14 -= l.y * x1; x14 -= l.z * x2; x14 -= l.w * x3; } { const v4f l = GDN_L4(14, 1); x14 -= l.x * x4; x14 -= l.y * x5; x14 -= l.z * x6; x14 -= l.w * x7; } { const v4f l = GDN_L4(14, 2); x14 -= l.x * x8; x14 -= l.y * x9; x14 -= l.z * x10; x14 -= l.w * x11; } { const v4f l = GDN_L4(14, 3); x14 -= l.x * x12; x14 -= l.y * x13; } __builtin_amdgcn_sched_barrier(0);
        float x15 = GDN_RHS(15); { const v4f l = GDN_L4(15, 0); x15 -= l.x * x0; x15 -= l.y * x1; x15 -= l.z * x2; x15 -= l.w * x3; } { const v4f l = GDN_L4(15, 1); x15 -= l.x * x4; x15 -= l.y * x5; x15 -= l.z * x6; x15 -= l.w * x7; } { const v4f l = GDN_L4(15, 2); x15 -= l.x * x8; x15 -= l.y * x9; x15 -= l.z * x10; x15 -= l.w * x11; } { const v4f l = GDN_L4(15, 3); x15 -= l.x * x12; x15 -= l.y * x13; x15 -= l.z * x14; } __builtin_amdgcn_sched_barrier(0);
        float x16 = GDN_RHS(16); { const v4f l = GDN_L4(16, 0); x16 -= l.x * x0; x16 -= l.y * x1; x16 -= l.z * x2; x16 -= l.w * x3; } { const v4f l = GDN_L4(16, 1); x16 -= l.x * x4; x16 -= l.y * x5; x16 -= l.z * x6; x16 -= l.w * x7; } { const v4f l = GDN_L4(16, 2); x16 -= l.x * x8; x16 -= l.y * x9; x16 -= l.z * x10; x16 -= l.w * x11; } { const v4f l = GDN_L4(16, 3); x16 -= l.x * x12; x16 -= l.y * x13; x16 -= l.z * x14; x16 -= l.w * x15; } __builtin_amdgcn_sched_barrier(0);
        float x17 = GDN_RHS(17); { const v4f l = GDN_L4(17, 0); x17 -= l.x * x0; x17 -= l.y * x1; x17 -= l.z * x2; x17 -= l.w * x3; } { const v4f l = GDN_L4(17, 1); x17 -= l.x * x4; x17 -= l.y * x5; x17 -= l.z * x6; x17 -= l.w * x7; } { const v4f l = GDN_L4(17, 2); x17 -= l.x * x8; x17 -= l.y * x9; x17 -= l.z * x10; x17 -= l.w * x11; } { const v4f l = GDN_L4(17, 3); x17 -= l.x * x12; x17 -= l.y * x13; x17 -= l.z * x14; x17 -= l.w * x15; } { const v4f l = GDN_L4(17, 4); x17 -= l.x * x16; } __builtin_amdgcn_sched_barrier(0);
        float x18 = GDN_RHS(18); { const v4f l = GDN_L4(18, 0); x18 -= l.x * x0; x18 -= l.y * x1; x18 -= l.z * x2; x18 -= l.w * x3; } { const v4f l = GDN_L4(18, 1); x18 -= l.x * x4; x18 -= l.y * x5; x18 -= l.z * x6; x18 -= l.w * x7; } { const v4f l = GDN_L4(18, 2); x18 -= l.x * x8; x18 -= l.y * x9; x18 -= l.z * x10; x18 -= l.w * x11; } { const v4f l = GDN_L4(18, 3); x18 -= l.x * x12; x18 -= l.y * x13; x18 -= l.z * x14; x18 -= l.w * x15; } { const v4f l = GDN_L4(18, 4); x18 -= l.x * x16; x18 -= l.y * x17; } __builtin_amdgcn_sched_barrier(0);
        float x19 = GDN_RHS(19); { const v4f l = GDN_L4(19, 0); x19 -= l.x * x0; x19 -= l.y * x1; x19 -= l.z * x2; x19 -= l.w * x3; } { const v4f l = GDN_L4(19, 1); x19 -= l.x * x4; x19 -= l.y * x5; x19 -= l.z * x6; x19 -= l.w * x7; } { const v4f l = GDN_L4(19, 2); x19 -= l.x * x8; x19 -= l.y * x9; x19 -= l.z * x10; x19 -= l.w * x11; } { const v4f l = GDN_L4(19, 3); x19 -= l.x * x12; x19 -= l.y * x13; x19 -= l.z * x14; x19 -= l.w * x15; } { const v4f l = GDN_L4(19, 4); x19 -= l.x * x16; x19 -= l.y * x17; x19 -= l.z * x18; } __builtin_amdgcn_sched_barrier(0);
        float x20 = GDN_RHS(20); { const v4f l = GDN_L4(20, 0); x20 -= l.x * x0; x20 -= l.y * x1; x20 -= l.z * x2; x20 -= l.w * x3; } { const v4f l = GDN_L4(20, 1); x20 -= l.x * x4; x20 -= l.y * x5; x20 -= l.z * x6; x20 -= l.w * x7; } { const v4f l = GDN_L4(20, 2); x20 -= l.x * x8; x20 -= l.y * x9; x20 -= l.z * x10; x20 -= l.w * x11; } { const v4f l = GDN_L4(20, 3); x20 -= l.x * x12; x20 -= l.y * x13; x20 -= l.z * x14; x20 -= l.w * x15; } { const v4f l = GDN_L4(20, 4); x20 -= l.x * x16; x20 -= l.y * x17; x20 -= l.z * x18; x20 -= l.w * x19; } __builtin_amdgcn_sched_barrier(0);
        float x21 = GDN_RHS(21); { const v4f l = GDN_L4(21, 0); x21 -= l.x * x0; x21 -= l.y * x1; x21 -= l.z * x2; x21 -= l.w * x3; } { const v4f l = GDN_L4(21, 1); x21 -= l.x * x4; x21 -= l.y * x5; x21 -= l.z * x6; x21 -= l.w * x7; } { const v4f l = GDN_L4(21, 2); x21 -= l.x * x8; x21 -= l.y * x9; x21 -= l.z * x10; x21 -= l.w * x11; } { const v4f l = GDN_L4(21, 3); x21 -= l.x * x12; x21 -= l.y * x13; x21 -= l.z * x14; x21 -= l.w * x15; } { const v4f l = GDN_L4(21, 4); x21 -= l.x * x16; x21 -= l.y * x17; x21 -= l.z * x18; x21 -= l.w * x19; } { const v4f l = GDN_L4(21, 5); x21 -= l.x * x20; } __builtin_amdgcn_sched_barrier(0);
        float x22 = GDN_RHS(22); { const v4f l = GDN_L4(22, 0); x22 -= l.x * x0; x22 -= l.y * x1; x22 -= l.z * x2; x22 -= l.w * x3; } { const v4f l = GDN_L4(22, 1); x22 -= l.x * x4; x22 -= l.y * x5; x22 -= l.z * x6; x22 -= l.w * x7; } { const v4f l = GDN_L4(22, 2); x22 -= l.x * x8; x22 -= l.y * x9; x22 -= l.z * x10; x22 -= l.w * x11; } { const v4f l = GDN_L4(22, 3); x22 -= l.x * x12; x22 -= l.y * x13; x22 -= l.z * x14; x22 -= l.w * x15; } { const v4f l = GDN_L4(22, 4); x22 -= l.x * x16; x22 -= l.y * x17; x22 -= l.z * x18; x22 -= l.w * x19; } { const v4f l = GDN_L4(22, 5); x22 -= l.x * x20; x22 -= l.y * x21; } __builtin_amdgcn_sched_barrier(0);
        float x23 = GDN_RHS(23); { const v4f l = GDN_L4(23, 0); x23 -= l.x * x0; x23 -= l.y * x1; x23 -= l.z * x2; x23 -= l.w * x3; } { const v4f l = GDN_L4(23, 1); x23 -= l.x * x4; x23 -= l.y * x5; x23 -= l.z * x6; x23 -= l.w * x7; } { const v4f l = GDN_L4(23, 2); x23 -= l.x * x8; x23 -= l.y * x9; x23 -= l.z * x10; x23 -= l.w * x11; } { const v4f l = GDN_L4(23, 3); x23 -= l.x * x12; x23 -= l.y * x13; x23 -= l.z * x14; x23 -= l.w * x15; } { const v4f l = GDN_L4(23, 4); x23 -= l.x * x16; x23 -= l.y * x17; x23 -= l.z * x18; x23 -= l.w * x19; } { const v4f l = GDN_L4(23, 5); x23 -= l.x * x20; x23 -= l.y * x21; x23 -= l.z * x22; } __builtin_amdgcn_sched_barrier(0);
        float x24 = GDN_RHS(24); { const v4f l = GDN_L4(24, 0); x24 -= l.x * x0; x24 -= l.y * x1; x24 -= l.z * x2; x24 -= l.w * x3; } { const v4f l = GDN_L4(24, 1); x24 -= l.x * x4; x24 -= l.y * x5; x24 -= l.z * x6; x24 -= l.w * x7; } { const v4f l = GDN_L4(24, 2); x24 -= l.x * x8; x24 -= l.y * x9; x24 -= l.z * x10; x24 -= l.w * x11; } { const v4f l = GDN_L4(24, 3); x24 -= l.x * x12; x24 -= l.y * x13; x24 -= l.z * x14; x24 -= l.w * x15; } { const v4f l = GDN_L4(24, 4); x24 -= l.x * x16; x24 -= l.y * x17; x24 -= l.z * x18; x24 -= l.w * x19; } { const v4f l = GDN_L4(24, 5); x24 -= l.x * x20; x24 -= l.y * x21; x24 -= l.z * x22; x24 -= l.w * x23; } __builtin_amdgcn_sched_barrier(0);
        float x25 = GDN_RHS(25); { const v4f l = GDN_L4(25, 0); x25 -= l.x * x0; x25 -= l.y * x1; x25 -= l.z * x2; x25 -= l.w * x3; } { const v4f l = GDN_L4(25, 1); x25 -= l.x * x4; x25 -= l.y * x5; x25 -= l.z * x6; x25 -= l.w * x7; } { const v4f l = GDN_L4(25, 2); x25 -= l.x * x8; x25 -= l.y * x9; x25 -= l.z * x10; x25 -= l.w * x11; } { const v4f l = GDN_L4(25, 3); x25 -= l.x * x12; x25 -= l.y * x13; x25 -= l.z * x14; x25 -= l.w * x15; } { const v4f l = GDN_L4(25, 4); x25 -= l.x * x16; x25 -= l.y * x17; x25 -= l.z * x18; x25 -= l.w * x19; } { const v4f l = GDN_L4(25, 5); x25 -= l.x * x20; x25 -= l.y * x21; x25 -= l.z * x22; x25 -= l.w * x23; } { const v4f l = GDN_L4(25, 6); x25 -= l.x * x24; } __builtin_amdgcn_sched_barrier(0);
        float x26 = GDN_RHS(26); { const v4f l = GDN_L4(26, 0); x26 -= l.x * x0; x26 -= l.y * x1; x26 -= l.z * x2; x26 -= l.w * x3; } { const v4f l = GDN_L4(26, 1); x26 -= l.x * x4; x26 -= l.y * x5; x26 -= l.z * x6; x26 -= l.w * x7; } { const v4f l = GDN_L4(26, 2); x26 -= l.x * x8; x26 -= l.y * x9; x26 -= l.z * x10; x26 -= l.w * x11; } { const v4f l = GDN_L4(26, 3); x26 -= l.x * x12; x26 -= l.y * x13; x26 -= l.z * x14; x26 -= l.w * x15; } { const v4f l = GDN_L4(26, 4); x26 -= l.x * x16; x26 -= l.y * x17; x26 -= l.z * x18; x26 -= l.w * x19; } { const v4f l = GDN_L4(26, 5); x26 -= l.x * x20; x26 -= l.y * x21; x26 -= l.z * x22; x26 -= l.w * x23; } { const v4f l = GDN_L4(26, 6); x26 -= l.x * x24; x26 -= l.y * x25; } __builtin_amdgcn_sched_barrier(0);
        float x27 = GDN_RHS(27); { const v4f l = GDN_L4(27, 0); x27 -= l.x * x0; x27 -= l.y * x1; x27 -= l.z * x2; x27 -= l.w * x3; } { const v4f l = GDN_L4(27, 1); x27 -= l.x * x4; x27 -= l.y * x5; x27 -= l.z * x6; x27 -= l.w * x7; } { const v4f l = GDN_L4(27, 2); x27 -= l.x * x8; x27 -= l.y * x9; x27 -= l.z * x10; x27 -= l.w * x11; } { const v4f l = GDN_L4(27, 3); x27 -= l.x * x12; x27 -= l.y * x13; x27 -= l.z * x14; x27 -= l.w * x15; } { const v4f l = GDN_L4(27, 4); x27 -= l.x * x16; x27 -= l.y * x17; x27 -= l.z * x18; x27 -= l.w * x19; } { const v4f l = GDN_L4(27, 5); x27 -= l.x * x20; x27 -= l.y * x21; x27 -= l.z * x22; x27 -= l.w * x23; } { const v4f l = GDN_L4(27, 6); x27 -= l.x * x24; x27 -= l.y * x25; x27 -= l.z * x26; } __builtin_amdgcn_sched_barrier(0);
        float x28 = GDN_RHS(28); { const v4f l = GDN_L4(28, 0); x28 -= l.x * x0; x28 -= l.y * x1; x28 -= l.z * x2; x28 -= l.w * x3; } { const v4f l = GDN_L4(28, 1); x28 -= l.x * x4; x28 -= l.y * x5; x28 -= l.z * x6; x28 -= l.w * x7; } { const v4f l = GDN_L4(28, 2); x28 -= l.x * x8; x28 -= l.y * x9; x28 -= l.z * x10; x28 -= l.w * x11; } { const v4f l = GDN_L4(28, 3); x28 -= l.x * x12; x28 -= l.y * x13; x28 -= l.z * x14; x28 -= l.w * x15; } { const v4f l = GDN_L4(28, 4); x28 -= l.x * x16; x28 -= l.y * x17; x28 -= l.z * x18; x28 -= l.w * x19; } { const v4f l = GDN_L4(28, 5); x28 -= l.x * x20; x28 -= l.y * x21; x28 -= l.z * x22; x28 -= l.w * x23; } { const v4f l = GDN_L4(28, 6); x28 -= l.x * x24; x28 -= l.y * x25; x28 -= l.z * x26; x28 -= l.w * x27; } __builtin_amdgcn_sched_barrier(0);
        float x29 = GDN_RHS(29); { const v4f l = GDN_L4(29, 0); x29 -= l.x * x0; x29 -= l.y * x1; x29 -= l.z * x2; x29 -= l.w * x3; } { const v4f l = GDN_L4(29, 1); x29 -= l.x * x4; x29 -= l.y * x5; x29 -= l.z * x6; x29 -= l.w * x7; } { const v4f l = GDN_L4(29, 2); x29 -= l.x * x8; x29 -= l.y * x9; x29 -= l.z * x10; x29 -= l.w * x11; } { const v4f l = GDN_L4(29, 3); x29 -= l.x * x12; x29 -= l.y * x13; x29 -= l.z * x14; x29 -= l.w * x15; } { const v4f l = GDN_L4(29, 4); x29 -= l.x * x16; x29 -= l.y * x17; x29 -= l.z * x18; x29 -= l.w * x19; } { const v4f l = GDN_L4(29, 5); x29 -= l.x * x20; x29 -= l.y * x21; x29 -= l.z * x22; x29 -= l.w * x23; } { const v4f l = GDN_L4(29, 6); x29 -= l.x * x24; x29 -= l.y * x25; x29 -= l.z * x26; x29 -= l.w * x27; } { const v4f l = GDN_L4(29, 7); x29 -= l.x * x28; } __builtin_amdgcn_sched_barrier(0);
        float x30 = GDN_RHS(30); { const v4f l = GDN_L4(30, 0); x30 -= l.x * x0; x30 -= l.y * x1; x30 -= l.z * x2; x30 -= l.w * x3; } { const v4f l = GDN_L4(30, 1); x30 -= l.x * x4; x30 -= l.y * x5; x30 -= l.z * x6; x30 -= l.w * x7; } { const v4f l = GDN_L4(30, 2); x30 -= l.x * x8; x30 -= l.y * x9; x30 -= l.z * x10; x30 -= l.w * x11; } { const v4f l = GDN_L4(30, 3); x30 -= l.x * x12; x30 -= l.y * x13; x30 -= l.z * x14; x30 -= l.w * x15; } { const v4f l = GDN_L4(30, 4); x30 -= l.x * x16; x30 -= l.y * x17; x30 -= l.z * x18; x30 -= l.w * x19; } { const v4f l = GDN_L4(30, 5); x30 -= l.x * x20; x30 -= l.y * x21; x30 -= l.z * x22; x30 -= l.w * x23; } { const v4f l = GDN_L4(30, 6); x30 -= l.x * x24; x30 -= l.y * x25; x30 -= l.z * x26; x30 -= l.w * x27; } { const v4f l = GDN_L4(30, 7); x30 -= l.x * x28; x30 -= l.y * x29; } __builtin_amdgcn_sched_barrier(0);
        float x31 = GDN_RHS(31); { const v4f l = GDN_L4(31, 0); x31 -= l.x * x0; x31 -= l.y * x1; x31 -= l.z * x2; x31 -= l.w * x3; } { const v4f l = GDN_L4(31, 1); x31 -= l.x * x4; x31 -= l.y * x5; x31 -= l.z * x6; x31 -= l.w * x7; } { const v4f l = GDN_L4(31, 2); x31 -= l.x * x8; x31 -= l.y * x9; x31 -= l.z * x10; x31 -= l.w * x11; } { const v4f l = GDN_L4(31, 3); x31 -= l.x * x12; x31 -= l.y * x13; x31 -= l.z * x14; x31 -= l.w * x15; } { const v4f l = GDN_L4(31, 4); x31 -= l.x * x16; x31 -= l.y * x17; x31 -= l.z * x18; x31 -= l.w * x19; } { const v4f l = GDN_L4(31, 5); x31 -= l.x * x20; x31 -= l.y * x21; x31 -= l.z * x22; x31 -= l.w * x23; } { const v4f l = GDN_L4(31, 6); x31 -= l.x * x24; x31 -= l.y * x25; x31 -= l.z * x26; x31 -= l.w * x27; } { const v4f l = GDN_L4(31, 7); x31 -= l.x * x28; x31 -= l.y * x29; x31 -= l.z * x30; } __builtin_amdgcn_sched_barrier(0);
        float x32 = GDN_RHS(32); { const v4f l = GDN_L4(32, 0); x32 -= l.x * x0; x32 -= l.y * x1; x32 -= l.z * x2; x32 -= l.w * x3; } { const v4f l = GDN_L4(32, 1); x32 -= l.x * x4; x32 -= l.y * x5; x32 -= l.z * x6; x32 -= l.w * x7; } { const v4f l = GDN_L4(32, 2); x32 -= l.x * x8; x32 -= l.y * x9; x32 -= l.z * x10; x32 -= l.w * x11; } { const v4f l = GDN_L4(32, 3); x32 -= l.x * x12; x32 -= l.y * x13; x32 -= l.z * x14; x32 -= l.w * x15; } { const v4f l = GDN_L4(32, 4); x32 -= l.x * x16; x32 -= l.y * x17; x32 -= l.z * x18; x32 -= l.w * x19; } { const v4f l = GDN_L4(32, 5); x32 -= l.x * x20; x32 -= l.y * x21; x32 -= l.z * x22; x32 -= l.w * x23; } { const v4f l = GDN_L4(32, 6); x32 -= l.x * x24; x32 -= l.y * x25; x32 -= l.z * x26; x32 -= l.w * x27; } { const v4f l = GDN_L4(32, 7); x32 -= l.x * x28; x32 -= l.y * x29; x32 -= l.z * x30; x32 -= l.w * x31; } __builtin_amdgcn_sched_barrier(0);
        float x33 = GDN_RHS(33); { const v4f l = GDN_L4(33, 0); x33 -= l.x * x0; x33 -= l.y * x1; x33 -= l.z * x2; x33 -= l.w * x3; } { const v4f l = GDN_L4(33, 1); x33 -= l.x * x4; x33 -= l.y * x5; x33 -= l.z * x6; x33 -= l.w * x7; } { const v4f l = GDN_L4(33, 2); x33 -= l.x * x8; x33 -= l.y * x9; x33 -= l.z * x10; x33 -= l.w * x11; } { const v4f l = GDN_L4(33, 3); x33 -= l.x * x12; x33 -= l.y * x13; x33 -= l.z * x14; x33 -= l.w * x15; } { const v4f l = GDN_L4(33, 4); x33 -= l.x * x16; x33 -= l.y * x17; x33 -= l.z * x18; x33 -= l.w * x19; } { const v4f l = GDN_L4(33, 5); x33 -= l.x * x20; x33 -= l.y * x21; x33 -= l.z * x22; x33 -= l.w * x23; } { const v4f l = GDN_L4(33, 6); x33 -= l.x * x24; x33 -= l.y * x25; x33 -= l.z * x26; x33 -= l.w * x27; } { const v4f l = GDN_L4(33, 7); x33 -= l.x * x28; x33 -= l.y * x29; x33 -= l.z * x30; x33 -= l.w * x31; } { const v4f l = GDN_L4(33, 8); x33 -= l.x * x32; } __builtin_amdgcn_sched_barrier(0);
        float x34 = GDN_RHS(34); { const v4f l = GDN_L4(34, 0); x34 -= l.x * x0; x34 -= l.y * x1; x34 -= l.z * x2; x34 -= l.w * x3; } { const v4f l = GDN_L4(34, 1); x34 -= l.x * x4; x34 -= l.y * x5; x34 -= l.z * x6; x34 -= l.w * x7; } { const v4f l = GDN_L4(34, 2); x34 -= l.x * x8; x34 -= l.y * x9; x34 -= l.z * x10; x34 -= l.w * x11; } { const v4f l = GDN_L4(34, 3); x34 -= l.x * x12; x34 -= l.y * x13; x34 -= l.z * x14; x34 -= l.w * x15; } { const v4f l = GDN_L4(34, 4); x34 -= l.x * x16; x34 -= l.y * x17; x34 -= l.z * x18; x34 -= l.w * x19; } { const v4f l = GDN_L4(34, 5); x34 -= l.x * x20; x34 -= l.y * x21; x34 -= l.z * x22; x34 -= l.w * x23; } { const v4f l = GDN_L4(34, 6); x34 -= l.x * x24; x34 -= l.y * x25; x34 -= l.z * x26; x34 -= l.w * x27; } { const v4f l = GDN_L4(34, 7); x34 -= l.x * x28; x34 -= l.y * x29; x34 -= l.z * x30; x34 -= l.w * x31; } { const v4f l = GDN_L4(34, 8); x34 -= l.x * x32; x34 -= l.y * x33; } __builtin_amdgcn_sched_barrier(0);
        float x35 = GDN_RHS(35); { const v4f l = GDN_L4(35, 0); x35 -= l.x * x0; x35 -= l.y * x1; x35 -= l.z * x2; x35 -= l.w * x3; } { const v4f l = GDN_L4(35, 1); x35 -= l.x * x4; x35 -= l.y * x5; x35 -= l.z * x6; x35 -= l.w * x7; } { const v4f l = GDN_L4(35, 2); x35 -= l.x * x8; x35 -= l.y * x9; x35 -= l.z * x10; x35 -= l.w * x11; } { const v4f l = GDN_L4(35, 3); x35 -= l.x * x12; x35 -= l.y * x13; x35 -= l.z * x14; x35 -= l.w * x15; } { const v4f l = GDN_L4(35, 4); x35 -= l.x * x16; x35 -= l.y * x17; x35 -= l.z * x18; x35 -= l.w * x19; } { const v4f l = GDN_L4(35, 5); x35 -= l.x * x20; x35 -= l.y * x21; x35 -= l.z * x22; x35 -= l.w * x23; } { const v4f l = GDN_L4(35, 6); x35 -= l.x * x24; x35 -= l.y * x25; x35 -= l.z * x26; x35 -= l.w * x27; } { const v4f l = GDN_L4(35, 7); x35 -= l.x * x28; x35 -= l.y * x29; x35 -= l.z * x30; x35 -= l.w * x31; } { const v4f l = GDN_L4(35, 8); x35 -= l.x * x32; x35 -= l.y * x33; x35 -= l.z * x34; } __builtin_amdgcn_sched_barrier(0);
        float x36 = GDN_RHS(36); { const v4f l = GDN_L4(36, 0); x36 -= l.x * x0; x36 -= l.y * x1; x36 -= l.z * x2; x36 -= l.w * x3; } { const v4f l = GDN_L4(36, 1); x36 -= l.x * x4; x36 -= l.y * x5; x36 -= l.z * x6; x36 -= l.w * x7; } { const v4f l = GDN_L4(36, 2); x36 -= l.x * x8; x36 -= l.y * x9; x36 -= l.z * x10; x36 -= l.w * x11; } { const v4f l = GDN_L4(36, 3); x36 -= l.x * x12; x36 -= l.y * x13; x36 -= l.z * x14; x36 -= l.w * x15; } { const v4f l = GDN_L4(36, 4); x36 -= l.x * x16; x36 -= l.y * x17; x36 -= l.z * x18; x36 -= l.w * x19; } { const v4f l = GDN_L4(36, 5); x36 -= l.x * x20; x36 -= l.y * x21; x36 -= l.z * x22; x36 -= l.w * x23; } { const v4f l = GDN_L4(36, 6); x36 -= l.x * x24; x36 -= l.y * x25; x36 -= l.z * x26; x36 -= l.w * x27; } { const v4f l = GDN_L4(36, 7); x36 -= l.x * x28; x36 -= l.y * x29; x36 -= l.z * x30; x36 -= l.w * x31; } { const v4f l = GDN_L4(36, 8); x36 -= l.x * x32; x36 -= l.y * x33; x36 -= l.z * x34; x36 -= l.w * x35; } __builtin_amdgcn_sched_barrier(0);
        float x37 = GDN_RHS(37); { const v4f l = GDN_L4(37, 0); x37 -= l.x * x0; x37 -= l.y * x1; x37 -= l.z * x2; x37 -= l.w * x3; } { const v4f l = GDN_L4(37, 1); x37 -= l.x * x4; x37 -= l.y * x5; x37 -= l.z * x6; x37 -= l.w * x7; } { const v4f l = GDN_L4(37, 2); x37 -= l.x * x8; x37 -= l.y * x9; x37 -= l.z * x10; x37 -= l.w * x11; } { const v4f l = GDN_L4(37, 3); x37 -= l.x * x12; x37 -= l.y * x13; x37 -= l.z * x14; x37 -= l.w * x15; } { const v4f l = GDN_L4(37, 4); x37 -= l.x * x16; x37 -= l.y * x17; x37 -= l.z * x18; x37 -= l.w * x19; } { const v4f l = GDN_L4(37, 5); x37 -= l.x * x20; x37 -= l.y * x21; x37 -= l.z * x22; x37 -= l.w * x23; } { const v4f l = GDN_L4(37, 6); x37 -= l.x * x24; x37 -= l.y * x25; x37 -= l.z * x26; x37 -= l.w * x27; } { const v4f l = GDN_L4(37, 7); x37 -= l.x * x28; x37 -= l.y * x29; x37 -= l.z * x30; x37 -= l.w * x31; } { const v4f l = GDN_L4(37, 8); x37 -= l.x * x32; x37 -= l.y * x33; x37 -= l.z * x34; x37 -= l.w * x35; } { const v4f l = GDN_L4(37, 9); x37 -= l.x * x36; } __builtin_amdgcn_sched_barrier(0);
        float x38 = GDN_RHS(38); { const v4f l = GDN_L4(38, 0); x38 -= l.x * x0; x38 -= l.y * x1; x38 -= l.z * x2; x38 -= l.w * x3; } { const v4f l = GDN_L4(38, 1); x38 -= l.x * x4; x38 -= l.y * x5; x38 -= l.z * x6; x38 -= l.w * x7; } { const v4f l = GDN_L4(38, 2); x38 -= l.x * x8; x38 -= l.y * x9; x38 -= l.z * x10; x38 -= l.w * x11; } { const v4f l = GDN_L4(38, 3); x38 -= l.x * x12; x38 -= l.y * x13; x38 -= l.z * x14; x38 -= l.w * x15; } { const v4f l = GDN_L4(38, 4); x38 -= l.x * x16; x38 -= l.y * x17; x38 -= l.z * x18; x38 -= l.w * x19; } { const v4f l = GDN_L4(38, 5); x38 -= l.x * x20; x38 -= l.y * x21; x38 -= l.z * x22; x38 -= l.w * x23; } { const v4f l = GDN_L4(38, 6); x38 -= l.x * x24; x38 -= l.y * x25; x38 -= l.z * x26; x38 -= l.w * x27; } { const v4f l = GDN_L4(38, 7); x38 -= l.x * x28; x38 -= l.y * x29; x38 -= l.z * x30; x38 -= l.w * x31; } { const v4f l = GDN_L4(38, 8); x38 -= l.x * x32; x38 -= l.y * x33; x38 -= l.z * x34; x38 -= l.w * x35; } { const v4f l = GDN_L4(38, 9); x38 -= l.x * x36; x38 -= l.y * x37; } __builtin_amdgcn_sched_barrier(0);
        float x39 = GDN_RHS(39); { const v4f l = GDN_L4(39, 0); x39 -= l.x * x0; x39 -= l.y * x1; x39 -= l.z * x2; x39 -= l.w * x3; } { const v4f l = GDN_L4(39, 1); x39 -= l.x * x4; x39 -= l.y * x5; x39 -= l.z * x6; x39 -= l.w * x7; } { const v4f l = GDN_L4(39, 2); x39 -= l.x * x8; x39 -= l.y * x9; x39 -= l.z * x10; x39 -= l.w * x11; } { const v4f l = GDN_L4(39, 3); x39 -= l.x * x12; x39 -= l.y * x13; x39 -= l.z * x14; x39 -= l.w * x15; } { const v4f l = GDN_L4(39, 4); x39 -= l.x * x16; x39 -= l.y * x17; x39 -= l.z * x18; x39 -= l.w * x19; } { const v4f l = GDN_L4(39, 5); x39 -= l.x * x20; x39 -= l.y * x21; x39 -= l.z * x22; x39 -= l.w * x23; } { const v4f l = GDN_L4(39, 6); x39 -= l.x * x24; x39 -= l.y * x25; x39 -= l.z * x26; x39 -= l.w * x27; } { const v4f l = GDN_L4(39, 7); x39 -= l.x * x28; x39 -= l.y * x29; x39 -= l.z * x30; x39 -= l.w * x31; } { const v4f l = GDN_L4(39, 8); x39 -= l.x * x32; x39 -= l.y * x33; x39 -= l.z * x34; x39 -= l.w * x35; } { const v4f l = GDN_L4(39, 9); x39 -= l.x * x36; x39 -= l.y * x37; x39 -= l.z * x38; } __builtin_amdgcn_sched_barrier(0);
        float x40 = GDN_RHS(40); { const v4f l = GDN_L4(40, 0); x40 -= l.x * x0; x40 -= l.y * x1; x40 -= l.z * x2; x40 -= l.w * x3; } { const v4f l = GDN_L4(40, 1); x40 -= l.x * x4; x40 -= l.y * x5; x40 -= l.z * x6; x40 -= l.w * x7; } { const v4f l = GDN_L4(40, 2); x40 -= l.x * x8; x40 -= l.y * x9; x40 -= l.z * x10; x40 -= l.w * x11; } { const v4f l = GDN_L4(40, 3); x40 -= l.x * x12; x40 -= l.y * x13; x40 -= l.z * x14; x40 -= l.w * x15; } { const v4f l = GDN_L4(40, 4); x40 -= l.x * x16; x40 -= l.y * x17; x40 -= l.z * x18; x40 -= l.w * x19; } { const v4f l = GDN_L4(40, 5); x40 -= l.x * x20; x40 -= l.y * x21; x40 -= l.z * x22; x40 -= l.w * x23; } { const v4f l = GDN_L4(40, 6); x40 -= l.x * x24; x40 -= l.y * x25; x40 -= l.z * x26; x40 -= l.w * x27; } { const v4f l = GDN_L4(40, 7); x40 -= l.x * x28; x40 -= l.y * x29; x40 -= l.z * x30; x40 -= l.w * x31; } { const v4f l = GDN_L4(40, 8); x40 -= l.x * x32; x40 -= l.y * x33; x40 -= l.z * x34; x40 -= l.w * x35; } { const v4f l = GDN_L4(40, 9); x40 -= l.x * x36; x40 -= l.y * x37; x40 -= l.z * x38; x40 -= l.w * x39; } __builtin_amdgcn_sched_barrier(0);
        float x41 = GDN_RHS(41); { const v4f l = GDN_L4(41, 0); x41 -= l.x * x0; x41 -= l.y * x1; x41 -= l.z * x2; x41 -= l.w * x3; } { const v4f l = GDN_L4(41, 1); x41 -= l.x * x4; x41 -= l.y * x5; x41 -= l.z * x6; x41 -= l.w * x7; } { const v4f l = GDN_L4(41, 2); x41 -= l.x * x8; x41 -= l.y * x9; x41 -= l.z * x10; x41 -= l.w * x11; } { const v4f l = GDN_L4(41, 3); x41 -= l.x * x12; x41 -= l.y * x13; x41 -= l.z * x14; x41 -= l.w * x15; } { const v4f l = GDN_L4(41, 4); x41 -= l.x * x16; x41 -= l.y * x17; x41 -= l.z * x18; x41 -= l.w * x19; } { const v4f l = GDN_L4(41, 5); x41 -= l.x * x20; x41 -= l.y * x21; x41 -= l.z * x22; x41 -= l.w * x23; } { const v4f l = GDN_L4(41, 6); x41 -= l.x * x24; x41 -= l.y * x25; x41 -= l.z * x26; x41 -= l.w * x27; } { const v4f l = GDN_L4(41, 7); x41 -= l.x * x28; x41 -= l.y * x29; x41 -= l.z * x30; x41 -= l.w * x31; } { const v4f l = GDN_L4(41, 8); x41 -= l.x * x32; x41 -= l.y * x33; x41 -= l.z * x34; x41 -= l.w * x35; } { const v4f l = GDN_L4(41, 9); x41 -= l.x * x36; x41 -= l.y * x37; x41 -= l.z * x38; x41 -= l.w * x39; } { const v4f l = GDN_L4(41, 10); x41 -= l.x * x40; } __builtin_amdgcn_sched_barrier(0);
        float x42 = GDN_RHS(42); { const v4f l = GDN_L4(42, 0); x42 -= l.x * x0; x42 -= l.y * x1; x42 -= l.z * x2; x42 -= l.w * x3; } { const v4f l = GDN_L4(42, 1); x42 -= l.x * x4; x42 -= l.y * x5; x42 -= l.z * x6; x42 -= l.w * x7; } { const v4f l = GDN_L4(42, 2); x42 -= l.x * x8; x42 -= l.y * x9; x42 -= l.z * x10; x42 -= l.w * x11; } { const v4f l = GDN_L4(42, 3); x42 -= l.x * x12; x42 -= l.y * x13; x42 -= l.z * x14; x42 -= l.w * x15; } { const v4f l = GDN_L4(42, 4); x42 -= l.x * x16; x42 -= l.y * x17; x42 -= l.z * x18; x42 -= l.w * x19; } { const v4f l = GDN_L4(42, 5); x42 -= l.x * x20; x42 -= l.y * x21; x42 -= l.z * x22; x42 -= l.w * x23; } { const v4f l = GDN_L4(42, 6); x42 -= l.x * x24; x42 -= l.y * x25; x42 -= l.z * x26; x42 -= l.w * x27; } { const v4f l = GDN_L4(42, 7); x42 -= l.x * x28; x42 -= l.y * x29; x42 -= l.z * x30; x42 -= l.w * x31; } { const v4f l = GDN_L4(42, 8); x42 -= l.x * x32; x42 -= l.y * x33; x42 -= l.z * x34; x42 -= l.w * x35; } { const v4f l = GDN_L4(42, 9); x42 -= l.x * x36; x42 -= l.y * x37; x42 -= l.z * x38; x42 -= l.w * x39; } { const v4f l = GDN_L4(42, 10); x42 -= l.x * x40; x42 -= l.y * x41; } __builtin_amdgcn_sched_barrier(0);
        float x43 = GDN_RHS(43); { const v4f l = GDN_L4(43, 0); x43 -= l.x * x0; x43 -= l.y * x1; x43 -= l.z * x2; x43 -= l.w * x3; } { const v4f l = GDN_L4(43, 1); x43 -= l.x * x4; x43 -= l.y * x5; x43 -= l.z * x6; x43 -= l.w * x7; } { const v4f l = GDN_L4(43, 2); x43 -= l.x * x8; x43 -= l.y * x9; x43 -= l.z * x10; x43 -= l.w * x11; } { const v4f l = GDN_L4(43, 3); x43 -= l.x * x12; x43 -= l.y * x13; x43 -= l.z * x14; x43 -= l.w * x15; } { const v4f l = GDN_L4(43, 4); x43 -= l.x * x16; x43 -= l.y * x17; x43 -= l.z * x18; x43 -= l.w * x19; } { const v4f l = GDN_L4(43, 5); x43 -= l.x * x20; x43 -= l.y * x21; x43 -= l.z * x22; x43 -= l.w * x23; } { const v4f l = GDN_L4(43, 6); x43 -= l.x * x24; x43 -= l.y * x25; x43 -= l.z * x26; x43 -= l.w * x27; } { const v4f l = GDN_L4(43, 7); x43 -= l.x * x28; x43 -= l.y * x29; x43 -= l.z * x30; x43 -= l.w * x31; } { const v4f l = GDN_L4(43, 8); x43 -= l.x * x32; x43 -= l.y * x33; x43 -= l.z * x34; x43 -= l.w * x35; } { const v4f l = GDN_L4(43, 9); x43 -= l.x * x36; x43 -= l.y * x37; x43 -= l.z * x38; x43 -= l.w * x39; } { const v4f l = GDN_L4(43, 10); x43 -= l.x * x40; x43 -= l.y * x41; x43 -= l.z * x42; } __builtin_amdgcn_sched_barrier(0);
        float x44 = GDN_RHS(44); { const v4f l = GDN_L4(44, 0); x44 -= l.x * x0; x44 -= l.y * x1; x44 -= l.z * x2; x44 -= l.w * x3; } { const v4f l = GDN_L4(44, 1); x44 -= l.x * x4; x44 -= l.y * x5; x44 -= l.z * x6; x44 -= l.w * x7; } { const v4f l = GDN_L4(44, 2); x44 -= l.x * x8; x44 -= l.y * x9; x44 -= l.z * x10; x44 -= l.w * x11; } { const v4f l = GDN_L4(44, 3); x44 -= l.x * x12; x44 -= l.y * x13; x44 -= l.z * x14; x44 -= l.w * x15; } { const v4f l = GDN_L4(44, 4); x44 -= l.x * x16; x44 -= l.y * x17; x44 -= l.z * x18; x44 -= l.w * x19; } { const v4f l = GDN_L4(44, 5); x44 -= l.x * x20; x44 -= l.y * x21; x44 -= l.z * x22; x44 -= l.w * x23; } { const v4f l = GDN_L4(44, 6); x44 -= l.x * x24; x44 -= l.y * x25; x44 -= l.z * x26; x44 -= l.w * x27; } { const v4f l = GDN_L4(44, 7); x44 -= l.x * x28; x44 -= l.y * x29; x44 -= l.z * x30; x44 -= l.w * x31; } { const v4f l = GDN_L4(44, 8); x44 -= l.x * x32; x44 -= l.y * x33; x44 -= l.z * x34; x44 -= l.w * x35; } { const v4f l = GDN_L4(44, 9); x44 -= l.x * x36; x44 -= l.y * x37; x44 -= l.z * x38; x44 -= l.w * x39; } { const v4f l = GDN_L4(44, 10); x44 -= l.x * x40; x44 -= l.y * x41; x44 -= l.z * x42; x44 -= l.w * x43; } __builtin_amdgcn_sched_barrier(0);
        float x45 = GDN_RHS(45); { const v4f l = GDN_L4(45, 0); x45 -= l.x * x0; x45 -= l.y * x1; x45 -= l.z * x2; x45 -= l.w * x3; } { const v4f l = GDN_L4(45, 1); x45 -= l.x * x4; x45 -= l.y * x5; x45 -= l.z * x6; x45 -= l.w * x7; } { const v4f l = GDN_L4(45, 2); x45 -= l.x * x8; x45 -= l.y * x9; x45 -= l.z * x10; x45 -= l.w * x11; } { const v4f l = GDN_L4(45, 3); x45 -= l.x * x12; x45 -= l.y * x13; x45 -= l.z * x14; x45 -= l.w * x15; } { const v4f l = GDN_L4(45, 4); x45 -= l.x * x16; x45 -= l.y * x17; x45 -= l.z * x18; x45 -= l.w * x19; } { const v4f l = GDN_L4(45, 5); x45 -= l.x * x20; x45 -= l.y * x21; x45 -= l.z * x22; x45 -= l.w * x23; } { const v4f l = GDN_L4(45, 6); x45 -= l.x * x24; x45 -= l.y * x25; x45 -= l.z * x26; x45 -= l.w * x27; } { const v4f l = GDN_L4(45, 7); x45 -= l.x * x28; x45 -= l.y * x29; x45 -= l.z * x30; x45 -= l.w * x31; } { const v4f l = GDN_L4(45, 8); x45 -= l.x * x32; x45 -= l.y * x33; x45 -= l.z * x34; x45 -= l.w * x35; } { const v4f l = GDN_L4(45, 9); x45 -= l.x * x36; x45 -= l.y * x37; x45 -= l.z * x38; x45 -= l.w * x39; } { const v4f l = GDN_L4(45, 10); x45 -= l.x * x40; x45 -= l.y * x41; x45 -= l.z * x42; x45 -= l.w * x43; } { const v4f l = GDN_L4(45, 11); x45 -= l.x * x44; } __builtin_amdgcn_sched_barrier(0);
        float x46 = GDN_RHS(46); { const v4f l = GDN_L4(46, 0); x46 -= l.x * x0; x46 -= l.y * x1; x46 -= l.z * x2; x46 -= l.w * x3; } { const v4f l = GDN_L4(46, 1); x46 -= l.x * x4; x46 -= l.y * x5; x46 -= l.z * x6; x46 -= l.w * x7; } { const v4f l = GDN_L4(46, 2); x46 -= l.x * x8; x46 -= l.y * x9; x46 -= l.z * x10; x46 -= l.w * x11; } { const v4f l = GDN_L4(46, 3); x46 -= l.x * x12; x46 -= l.y * x13; x46 -= l.z * x14; x46 -= l.w * x15; } { const v4f l = GDN_L4(46, 4); x46 -= l.x * x16; x46 -= l.y * x17; x46 -= l.z * x18; x46 -= l.w * x19; } { const v4f l = GDN_L4(46, 5); x46 -= l.x * x20; x46 -= l.y * x21; x46 -= l.z * x22; x46 -= l.w * x23; } { const v4f l = GDN_L4(46, 6); x46 -= l.x * x24; x46 -= l.y * x25; x46 -= l.z * x26; x46 -= l.w * x27; } { const v4f l = GDN_L4(46, 7); x46 -= l.x * x28; x46 -= l.y * x29; x46 -= l.z * x30; x46 -= l.w * x31; } { const v4f l = GDN_L4(46, 8); x46 -= l.x * x32; x46 -= l.y * x33; x46 -= l.z * x34; x46 -= l.w * x35; } { const v4f l = GDN_L4(46, 9); x46 -= l.x * x36; x46 -= l.y * x37; x46 -= l.z * x38; x46 -= l.w * x39; } { const v4f l = GDN_L4(46, 10); x46 -= l.x * x40; x46 -= l.y * x41; x46 -= l.z * x42; x46 -= l.w * x43; } { const v4f l = GDN_L4(46, 11); x46 -= l.x * x44; x46 -= l.y * x45; } __builtin_amdgcn_sched_barrier(0);
        float x47 = GDN_RHS(47); { const v4f l = GDN_L4(47, 0); x47 -= l.x * x0; x47 -= l.y * x1; x47 -= l.z * x2; x47 -= l.w * x3; } { const v4f l = GDN_L4(47, 1); x47 -= l.x * x4; x47 -= l.y * x5; x47 -= l.z * x6; x47 -= l.w * x7; } { const v4f l = GDN_L4(47, 2); x47 -= l.x * x8; x47 -= l.y * x9; x47 -= l.z * x10; x47 -= l.w * x11; } { const v4f l = GDN_L4(47, 3); x47 -= l.x * x12; x47 -= l.y * x13; x47 -= l.z * x14; x47 -= l.w * x15; } { const v4f l = GDN_L4(47, 4); x47 -= l.x * x16; x47 -= l.y * x17; x47 -= l.z * x18; x47 -= l.w * x19; } { const v4f l = GDN_L4(47, 5); x47 -= l.x * x20; x47 -= l.y * x21; x47 -= l.z * x22; x47 -= l.w * x23; } { const v4f l = GDN_L4(47, 6); x47 -= l.x * x24; x47 -= l.y * x25; x47 -= l.z * x26; x47 -= l.w * x27; } { const v4f l = GDN_L4(47, 7); x47 -= l.x * x28; x47 -= l.y * x29; x47 -= l.z * x30; x47 -= l.w * x31; } { const v4f l = GDN_L4(47, 8); x47 -= l.x * x32; x47 -= l.y * x33; x47 -= l.z * x34; x47 -= l.w * x35; } { const v4f l = GDN_L4(47, 9); x47 -= l.x * x36; x47 -= l.y * x37; x47 -= l.z * x38; x47 -= l.w * x39; } { const v4f l = GDN_L4(47, 10); x47 -= l.x * x40; x47 -= l.y * x41; x47 -= l.z * x42; x47 -= l.w * x43; } { const v4f l = GDN_L4(47, 11); x47 -= l.x * x44; x47 -= l.y * x45; x47 -= l.z * x46; } __builtin_amdgcn_sched_barrier(0);
        float x48 = GDN_RHS(48); { const v4f l = GDN_L4(48, 0); x48 -= l.x * x0; x48 -= l.y * x1; x48 -= l.z * x2; x48 -= l.w * x3; } { const v4f l = GDN_L4(48, 1); x48 -= l.x * x4; x48 -= l.y * x5; x48 -= l.z * x6; x48 -= l.w * x7; } { const v4f l = GDN_L4(48, 2); x48 -= l.x * x8; x48 -= l.y * x9; x48 -= l.z * x10; x48 -= l.w * x11; } { const v4f l = GDN_L4(48, 3); x48 -= l.x * x12; x48 -= l.y * x13; x48 -= l.z * x14; x48 -= l.w * x15; } { const v4f l = GDN_L4(48, 4); x48 -= l.x * x16; x48 -= l.y * x17; x48 -= l.z * x18; x48 -= l.w * x19; } { const v4f l = GDN_L4(48, 5); x48 -= l.x * x20; x48 -= l.y * x21; x48 -= l.z * x22; x48 -= l.w * x23; } { const v4f l = GDN_L4(48, 6); x48 -= l.x * x24; x48 -= l.y * x25; x48 -= l.z * x26; x48 -= l.w * x27; } { const v4f l = GDN_L4(48, 7); x48 -= l.x * x28; x48 -= l.y * x29; x48 -= l.z * x30; x48 -= l.w * x31; } { const v4f l = GDN_L4(48, 8); x48 -= l.x * x32; x48 -= l.y * x33; x48 -= l.z * x34; x48 -= l.w * x35; } { const v4f l = GDN_L4(48, 9); x48 -= l.x * x36; x48 -= l.y * x37; x48 -= l.z * x38; x48 -= l.w * x39; } { const v4f l = GDN_L4(48, 10); x48 -= l.x * x40; x48 -= l.y * x41; x48 -= l.z * x42; x48 -= l.w * x43; } { const v4f l = GDN_L4(48, 11); x48 -= l.x * x44; x48 -= l.y * x45; x48 -= l.z * x46; x48 -= l.w * x47; } __builtin_amdgcn_sched_barrier(0);
        float x49 = GDN_RHS(49); { const v4f l = GDN_L4(49, 0); x49 -= l.x * x0; x49 -= l.y * x1; x49 -= l.z * x2; x49 -= l.w * x3; } { const v4f l = GDN_L4(49, 1); x49 -= l.x * x4; x49 -= l.y * x5; x49 -= l.z * x6; x49 -= l.w * x7; } { const v4f l = GDN_L4(49, 2); x49 -= l.x * x8; x49 -= l.y * x9; x49 -= l.z * x10; x49 -= l.w * x11; } { const v4f l = GDN_L4(49, 3); x49 -= l.x * x12; x49 -= l.y * x13; x49 -= l.z * x14; x49 -= l.w * x15; } { const v4f l = GDN_L4(49, 4); x49 -= l.x * x16; x49 -= l.y * x17; x49 -= l.z * x18; x49 -= l.w * x19; } { const v4f l = GDN_L4(49, 5); x49 -= l.x * x20; x49 -= l.y * x21; x49 -= l.z * x22; x49 -= l.w * x23; } { const v4f l = GDN_L4(49, 6); x49 -= l.x * x24; x49 -= l.y * x25; x49 -= l.z * x26; x49 -= l.w * x27; } { const v4f l = GDN_L4(49, 7); x49 -= l.x * x28; x49 -= l.y * x29; x49 -= l.z * x30; x49 -= l.w * x31; } { const v4f l = GDN_L4(49, 8); x49 -= l.x * x32; x49 -= l.y * x33; x49 -= l.z * x34; x49 -= l.w * x35; } { const v4f l = GDN_L4(49, 9); x49 -= l.x * x36; x49 -= l.y * x37; x49 -= l.z * x38; x49 -= l.w * x39; } { const v4f l = GDN_L4(49, 10); x49 -= l.x * x40; x49 -= l.y * x41; x49 -= l.z * x42; x49 -= l.w * x43; } { const v4f l = GDN_L4(49, 11); x49 -= l.x * x44; x49 -= l.y * x45; x49 -= l.z * x46; x49 -= l.w * x47; } { const v4f l = GDN_L4(49, 12); x49 -= l.x * x48; } __builtin_amdgcn_sched_barrier(0);
        float x50 = GDN_RHS(50); { const v4f l = GDN_L4(50, 0); x50 -= l.x * x0; x50 -= l.y * x1; x50 -= l.z * x2; x50 -= l.w * x3; } { const v4f l = GDN_L4(50, 1); x50 -= l.x * x4; x50 -= l.y * x5; x50 -= l.z * x6; x50 -= l.w * x7; } { const v4f l = GDN_L4(50, 2); x50 -= l.x * x8; x50 -= l.y * x9; x50 -= l.z * x10; x50 -= l.w * x11; } { const v4f l = GDN_L4(50, 3); x50 -= l.x * x12; x50 -= l.y * x13; x50 -= l.z * x14; x50 -= l.w * x15; } { const v4f l = GDN_L4(50, 4); x50 -= l.x * x16; x50 -= l.y * x17; x50 -= l.z * x18; x50 -= l.w * x19; } { const v4f l = GDN_L4(50, 5); x50 -= l.x * x20; x50 -= l.y * x21; x50 -= l.z * x22; x50 -= l.w * x23; } { const v4f l = GDN_L4(50, 6); x50 -= l.x * x24; x50 -= l.y * x25; x50 -= l.z * x26; x50 -= l.w * x27; } { const v4f l = GDN_L4(50, 7); x50 -= l.x * x28; x50 -= l.y * x29; x50 -= l.z * x30; x50 -= l.w * x31; } { const v4f l = GDN_L4(50, 8); x50 -= l.x * x32; x50 -= l.y * x33; x50 -= l.z * x34; x50 -= l.w * x35; } { const v4f l = GDN_L4(50, 9); x50 -= l.x * x36; x50 -= l.y * x37; x50 -= l.z * x38; x50 -= l.w * x39; } { const v4f l = GDN_L4(50, 10); x50 -= l.x * x40; x50 -= l.y * x41; x50 -= l.z * x42; x50 -= l.w * x43; } { const v4f l = GDN_L4(50, 11); x50 -= l.x * x44; x50 -= l.y * x45; x50 -= l.z * x46; x50 -= l.w * x47; } { const v4f l = GDN_L4(50, 12); x50 -= l.x * x48; x50 -= l.y * x49; } __builtin_amdgcn_sched_barrier(0);
        float x51 = GDN_RHS(51); { const v4f l = GDN_L4(51, 0); x51 -= l.x * x0; x51 -= l.y * x1; x51 -= l.z * x2; x51 -= l.w * x3; } { const v4f l = GDN_L4(51, 1); x51 -= l.x * x4; x51 -= l.y * x5; x51 -= l.z * x6; x51 -= l.w * x7; } { const v4f l = GDN_L4(51, 2); x51 -= l.x * x8; x51 -= l.y * x9; x51 -= l.z * x10; x51 -= l.w * x11; } { const v4f l = GDN_L4(51, 3); x51 -= l.x * x12; x51 -= l.y * x13; x51 -= l.z * x14; x51 -= l.w * x15; } { const v4f l = GDN_L4(51, 4); x51 -= l.x * x16; x51 -= l.y * x17; x51 -= l.z * x18; x51 -= l.w * x19; } { const v4f l = GDN_L4(51, 5); x51 -= l.x * x20; x51 -= l.y * x21; x51 -= l.z * x22; x51 -= l.w * x23; } { const v4f l = GDN_L4(51, 6); x51 -= l.x * x24; x51 -= l.y * x25; x51 -= l.z * x26; x51 -= l.w * x27; } { const v4f l = GDN_L4(51, 7); x51 -= l.x * x28; x51 -= l.y * x29; x51 -= l.z * x30; x51 -= l.w * x31; } { const v4f l = GDN_L4(51, 8); x51 -= l.x * x32; x51 -= l.y * x33; x51 -= l.z * x34; x51 -= l.w * x35; } { const v4f l = GDN_L4(51, 9); x51 -= l.x * x36; x51 -= l.y * x37; x51 -= l.z * x38; x51 -= l.w * x39; } { const v4f l = GDN_L4(51, 10); x51 -= l.x * x40; x51 -= l.y * x41; x51 -= l.z * x42; x51 -= l.w * x43; } { const v4f l = GDN_L4(51, 11); x51 -= l.x * x44; x51 -= l.y * x45; x51 -= l.z * x46; x51 -= l.w * x47; } { const v4f l = GDN_L4(51, 12); x51 -= l.x * x48; x51 -= l.y * x49; x51 -= l.z * x50; } __builtin_amdgcn_sched_barrier(0);
        float x52 = GDN_RHS(52); { const v4f l = GDN_L4(52, 0); x52 -= l.x * x0; x52 -= l.y * x1; x52 -= l.z * x2; x52 -= l.w * x3; } { const v4f l = GDN_L4(52, 1); x52 -= l.x * x4; x52 -= l.y * x5; x52 -= l.z * x6; x52 -= l.w * x7; } { const v4f l = GDN_L4(52, 2); x52 -= l.x * x8; x52 -= l.y * x9; x52 -= l.z * x10; x52 -= l.w * x11; } { const v4f l = GDN_L4(52, 3); x52 -= l.x * x12; x52 -= l.y * x13; x52 -= l.z * x14; x52 -= l.w * x15; } { const v4f l = GDN_L4(52, 4); x52 -= l.x * x16; x52 -= l.y * x17; x52 -= l.z * x18; x52 -= l.w * x19; } { const v4f l = GDN_L4(52, 5); x52 -= l.x * x20; x52 -= l.y * x21; x52 -= l.z * x22; x52 -= l.w * x23; } { const v4f l = GDN_L4(52, 6); x52 -= l.x * x24; x52 -= l.y * x25; x52 -= l.z * x26; x52 -= l.w * x27; } { const v4f l = GDN_L4(52, 7); x52 -= l.x * x28; x52 -= l.y * x29; x52 -= l.z * x30; x52 -= l.w * x31; } { const v4f l = GDN_L4(52, 8); x52 -= l.x * x32; x52 -= l.y * x33; x52 -= l.z * x34; x52 -= l.w * x35; } { const v4f l = GDN_L4(52, 9); x52 -= l.x * x36; x52 -= l.y * x37; x52 -= l.z * x38; x52 -= l.w * x39; } { const v4f l = GDN_L4(52, 10); x52 -= l.x * x40; x52 -= l.y * x41; x52 -= l.z * x42; x52 -= l.w * x43; } { const v4f l = GDN_L4(52, 11); x52 -= l.x * x44; x52 -= l.y * x45; x52 -= l.z * x46; x52 -= l.w * x47; } { const v4f l = GDN_L4(52, 12); x52 -= l.x * x48; x52 -= l.y * x49; x52 -= l.z * x50; x52 -= l.w * x51; } __builtin_amdgcn_sched_barrier(0);
        float x53 = GDN_RHS(53); { const v4f l = GDN_L4(53, 0); x53 -= l.x * x0; x53 -= l.y * x1; x53 -= l.z * x2; x53 -= l.w * x3; } { const v4f l = GDN_L4(53, 1); x53 -= l.x * x4; x53 -= l.y * x5; x53 -= l.z * x6; x53 -= l.w * x7; } { const v4f l = GDN_L4(53, 2); x53 -= l.x * x8; x53 -= l.y * x9; x53 -= l.z * x10; x53 -= l.w * x11; } { const v4f l = GDN_L4(53, 3); x53 -= l.x * x12; x53 -= l.y * x13; x53 -= l.z * x14; x53 -= l.w * x15; } { const v4f l = GDN_L4(53, 4); x53 -= l.x * x16; x53 -= l.y * x17; x53 -= l.z * x18; x53 -= l.w * x19; } { const v4f l = GDN_L4(53, 5); x53 -= l.x * x20; x53 -= l.y * x21; x53 -= l.z * x22; x53 -= l.w * x23; } { const v4f l = GDN_L4(53, 6); x53 -= l.x * x24; x53 -= l.y * x25; x53 -= l.z * x26; x53 -= l.w * x27; } { const v4f l = GDN_L4(53, 7); x53 -= l.x * x28; x53 -= l.y * x29; x53 -= l.z * x30; x53 -= l.w * x31; } { const v4f l = GDN_L4(53, 8); x53 -= l.x * x32; x53 -= l.y * x33; x53 -= l.z * x34; x53 -= l.w * x35; } { const v4f l = GDN_L4(53, 9); x53 -= l.x * x36; x53 -= l.y * x37; x53 -= l.z * x38; x53 -= l.w * x39; } { const v4f l = GDN_L4(53, 10); x53 -= l.x * x40; x53 -= l.y * x41; x53 -= l.z * x42; x53 -= l.w * x43; } { const v4f l = GDN_L4(53, 11); x53 -= l.x * x44; x53 -= l.y * x45; x53 -= l.z * x46; x53 -= l.w * x47; } { const v4f l = GDN_L4(53, 12); x53 -= l.x * x48; x53 -= l.y * x49; x53 -= l.z * x50; x53 -= l.w * x51; } { const v4f l = GDN_L4(53, 13); x53 -= l.x * x52; } __builtin_amdgcn_sched_barrier(0);
        float x54 = GDN_RHS(54); { const v4f l = GDN_L4(54, 0); x54 -= l.x * x0; x54 -= l.y * x1; x54 -= l.z * x2; x54 -= l.w * x3; } { const v4f l = GDN_L4(54, 1); x54 -= l.x * x4; x54 -= l.y * x5; x54 -= l.z * x6; x54 -= l.w * x7; } { const v4f l = GDN_L4(54, 2); x54 -= l.x * x8; x54 -= l.y * x9; x54 -= l.z * x10; x54 -= l.w * x11; } { const v4f l = GDN_L4(54, 3); x54 -= l.x * x12; x54 -= l.y * x13; x54 -= l.z * x14; x54 -= l.w * x15; } { const v4f l = GDN_L4(54, 4); x54 -= l.x * x16; x54 -= l.y * x17; x54 -= l.z * x18; x54 -= l.w * x19; } { const v4f l = GDN_L4(54, 5); x54 -= l.x * x20; x54 -= l.y * x21; x54 -= l.z * x22; x54 -= l.w * x23; } { const v4f l = GDN_L4(54, 6); x54 -= l.x * x24; x54 -= l.y * x25; x54 -= l.z * x26; x54 -= l.w * x27; } { const v4f l = GDN_L4(54, 7); x54 -= l.x * x28; x54 -= l.y * x29; x54 -= l.z * x30; x54 -= l.w * x31; } { const v4f l = GDN_L4(54, 8); x54 -= l.x * x32; x54 -= l.y * x33; x54 -= l.z * x34; x54 -= l.w * x35; } { const v4f l = GDN_L4(54, 9); x54 -= l.x * x36; x54 -= l.y * x37; x54 -= l.z * x38; x54 -= l.w * x39; } { const v4f l = GDN_L4(54, 10); x54 -= l.x * x40; x54 -= l.y * x41; x54 -= l.z * x42; x54 -= l.w * x43; } { const v4f l = GDN_L4(54, 11); x54 -= l.x * x44; x54 -= l.y * x45; x54 -= l.z * x46; x54 -= l.w * x47; } { const v4f l = GDN_L4(54, 12); x54 -= l.x * x48; x54 -= l.y * x49; x54 -= l.z * x50; x54 -= l.w * x51; } { const v4f l = GDN_L4(54, 13); x54 -= l.x * x52; x54 -= l.y * x53; } __builtin_amdgcn_sched_barrier(0);
        float x55 = GDN_RHS(55); { const v4f l = GDN_L4(55, 0); x55 -= l.x * x0; x55 -= l.y * x1; x55 -= l.z * x2; x55 -= l.w * x3; } { const v4f l = GDN_L4(55, 1); x55 -= l.x * x4; x55 -= l.y * x5; x55 -= l.z * x6; x55 -= l.w * x7; } { const v4f l = GDN_L4(55, 2); x55 -= l.x * x8; x55 -= l.y * x9; x55 -= l.z * x10; x55 -= l.w * x11; } { const v4f l = GDN_L4(55, 3); x55 -= l.x * x12; x55 -= l.y * x13; x55 -= l.z * x14; x55 -= l.w * x15; } { const v4f l = GDN_L4(55, 4); x55 -= l.x * x16; x55 -= l.y * x17; x55 -= l.z * x18; x55 -= l.w * x19; } { const v4f l = GDN_L4(55, 5); x55 -= l.x * x20; x55 -= l.y * x21; x55 -= l.z * x22; x55 -= l.w * x23; } { const v4f l = GDN_L4(55, 6); x55 -= l.x * x24; x55 -= l.y * x25; x55 -= l.z * x26; x55 -= l.w * x27; } { const v4f l = GDN_L4(55, 7); x55 -= l.x * x28; x55 -= l.y * x29; x55 -= l.z * x30; x55 -= l.w * x31; } { const v4f l = GDN_L4(55, 8); x55 -= l.x * x32; x55 -= l.y * x33; x55 -= l.z * x34; x55 -= l.w * x35; } { const v4f l = GDN_L4(55, 9); x55 -= l.x * x36; x55 -= l.y * x37; x55 -= l.z * x38; x55 -= l.w * x39; } { const v4f l = GDN_L4(55, 10); x55 -= l.x * x40; x55 -= l.y * x41; x55 -= l.z * x42; x55 -= l.w * x43; } { const v4f l = GDN_L4(55, 11); x55 -= l.x * x44; x55 -= l.y * x45; x55 -= l.z * x46; x55 -= l.w * x47; } { const v4f l = GDN_L4(55, 12); x55 -= l.x * x48; x55 -= l.y * x49; x55 -= l.z * x50; x55 -= l.w * x51; } { const v4f l = GDN_L4(55, 13); x55 -= l.x * x52; x55 -= l.y * x53; x55 -= l.z * x54; } __builtin_amdgcn_sched_barrier(0);
        float x56 = GDN_RHS(56); { const v4f l = GDN_L4(56, 0); x56 -= l.x * x0; x56 -= l.y * x1; x56 -= l.z * x2; x56 -= l.w * x3; } { const v4f l = GDN_L4(56, 1); x56 -= l.x * x4; x56 -= l.y * x5; x56 -= l.z * x6; x56 -= l.w * x7; } { const v4f l = GDN_L4(56, 2); x56 -= l.x * x8; x56 -= l.y * x9; x56 -= l.z * x10; x56 -= l.w * x11; } { const v4f l = GDN_L4(56, 3); x56 -= l.x * x12; x56 -= l.y * x13; x56 -= l.z * x14; x56 -= l.w * x15; } { const v4f l = GDN_L4(56, 4); x56 -= l.x * x16; x56 -= l.y * x17; x56 -= l.z * x18; x56 -= l.w * x19; } { const v4f l = GDN_L4(56, 5); x56 -= l.x * x20; x56 -= l.y * x21; x56 -= l.z * x22; x56 -= l.w * x23; } { const v4f l = GDN_L4(56, 6); x56 -= l.x * x24; x56 -= l.y * x25; x56 -= l.z * x26; x56 -= l.w * x27; } { const v4f l = GDN_L4(56, 7); x56 -= l.x * x28; x56 -= l.y * x29; x56 -= l.z * x30; x56 -= l.w * x31; } { const v4f l = GDN_L4(56, 8); x56 -= l.x * x32; x56 -= l.y * x33; x56 -= l.z * x34; x56 -= l.w * x35; } { const v4f l = GDN_L4(56, 9); x56 -= l.x * x36; x56 -= l.y * x37; x56 -= l.z * x38; x56 -= l.w * x39; } { const v4f l = GDN_L4(56, 10); x56 -= l.x * x40; x56 -= l.y * x41; x56 -= l.z * x42; x56 -= l.w * x43; } { const v4f l = GDN_L4(56, 11); x56 -= l.x * x44; x56 -= l.y * x45; x56 -= l.z * x46; x56 -= l.w * x47; } { const v4f l = GDN_L4(56, 12); x56 -= l.x * x48; x56 -= l.y * x49; x56 -= l.z * x50; x56 -= l.w * x51; } { const v4f l = GDN_L4(56, 13); x56 -= l.x * x52; x56 -= l.y * x53; x56 -= l.z * x54; x56 -= l.w * x55; } __builtin_amdgcn_sched_barrier(0);
        float x57 = GDN_RHS(57); { const v4f l = GDN_L4(57, 0); x57 -= l.x * x0; x57 -= l.y * x1; x57 -= l.z * x2; x57 -= l.w * x3; } { const v4f l = GDN_L4(57, 1); x57 -= l.x * x4; x57 -= l.y * x5; x57 -= l.z * x6; x57 -= l.w * x7; } { const v4f l = GDN_L4(57, 2); x57 -= l.x * x8; x57 -= l.y * x9; x57 -= l.z * x10; x57 -= l.w * x11; } { const v4f l = GDN_L4(57, 3); x57 -= l.x * x12; x57 -= l.y * x13; x57 -= l.z * x14; x57 -= l.w * x15; } { const v4f l = GDN_L4(57, 4); x57 -= l.x * x16; x57 -= l.y * x17; x57 -= l.z * x18; x57 -= l.w * x19; } { const v4f l = GDN_L4(57, 5); x57 -= l.x * x20; x57 -= l.y * x21; x57 -= l.z * x22; x57 -= l.w * x23; } { const v4f l = GDN_L4(57, 6); x57 -= l.x * x24; x57 -= l.y * x25; x57 -= l.z * x26; x57 -= l.w * x27; } { const v4f l = GDN_L4(57, 7); x57 -= l.x * x28; x57 -= l.y * x29; x57 -= l.z * x30; x57 -= l.w * x31; } { const v4f l = GDN_L4(57, 8); x57 -= l.x * x32; x57 -= l.y * x33; x57 -= l.z * x34; x57 -= l.w * x35; } { const v4f l = GDN_L4(57, 9); x57 -= l.x * x36; x57 -= l.y * x37; x57 -= l.z * x38; x57 -= l.w * x39; } { const v4f l = GDN_L4(57, 10); x57 -= l.x * x40; x57 -= l.y * x41; x57 -= l.z * x42; x57 -= l.w * x43; } { const v4f l = GDN_L4(57, 11); x57 -= l.x * x44; x57 -= l.y * x45; x57 -= l.z * x46; x57 -= l.w * x47; } { const v4f l = GDN_L4(57, 12); x57 -= l.x * x48; x57 -= l.y * x49; x57 -= l.z * x50; x57 -= l.w * x51; } { const v4f l = GDN_L4(57, 13); x57 -= l.x * x52; x57 -= l.y * x53; x57 -= l.z * x54; x57 -= l.w * x55; } { const v4f l = GDN_L4(57, 14); x57 -= l.x * x56; } __builtin_amdgcn_sched_barrier(0);
        float x58 = GDN_RHS(58); { const v4f l = GDN_L4(58, 0); x58 -= l.x * x0; x58 -= l.y * x1; x58 -= l.z * x2; x58 -= l.w * x3; } { const v4f l = GDN_L4(58, 1); x58 -= l.x * x4; x58 -= l.y * x5; x58 -= l.z * x6; x58 -= l.w * x7; } { const v4f l = GDN_L4(58, 2); x58 -= l.x * x8; x58 -= l.y * x9; x58 -= l.z * x10; x58 -= l.w * x11; } { const v4f l = GDN_L4(58, 3); x58 -= l.x * x12; x58 -= l.y * x13; x58 -= l.z * x14; x58 -= l.w * x15; } { const v4f l = GDN_L4(58, 4); x58 -= l.x * x16; x58 -= l.y * x17; x58 -= l.z * x18; x58 -= l.w * x19; } { const v4f l = GDN_L4(58, 5); x58 -= l.x * x20; x58 -= l.y * x21; x58 -= l.z * x22; x58 -= l.w * x23; } { const v4f l = GDN_L4(58, 6); x58 -= l.x * x24; x58 -= l.y * x25; x58 -= l.z * x26; x58 -= l.w * x27; } { const v4f l = GDN_L4(58, 7); x58 -= l.x * x28; x58 -= l.y * x29; x58 -= l.z * x30; x58 -= l.w * x31; } { const v4f l = GDN_L4(58, 8); x58 -= l.x * x32; x58 -= l.y * x33; x58 -= l.z * x34; x58 -= l.w * x35; } { const v4f l = GDN_L4(58, 9); x58 -= l.x * x36; x58 -= l.y * x37; x58 -= l.z * x38; x58 -= l.w * x39; } { const v4f l = GDN_L4(58, 10); x58 -= l.x * x40; x58 -= l.y * x41; x58 -= l.z * x42; x58 -= l.w * x43; } { const v4f l = GDN_L4(58, 11); x58 -= l.x * x44; x58 -= l.y * x45; x58 -= l.z * x46; x58 -= l.w * x47; } { const v4f l = GDN_L4(58, 12); x58 -= l.x * x48; x58 -= l.y * x49; x58 -= l.z * x50; x58 -= l.w * x51; } { const v4f l = GDN_L4(58, 13); x58 -= l.x * x52; x58 -= l.y * x53; x58 -= l.z * x54; x58 -= l.w * x55; } { const v4f l = GDN_L4(58, 14); x58 -= l.x * x56; x58 -= l.y * x57; } __builtin_amdgcn_sched_barrier(0);
        float x59 = GDN_RHS(59); { const v4f l = GDN_L4(59, 0); x59 -= l.x * x0; x59 -= l.y * x1; x59 -= l.z * x2; x59 -= l.w * x3; } { const v4f l = GDN_L4(59, 1); x59 -= l.x * x4; x59 -= l.y * x5; x59 -= l.z * x6; x59 -= l.w * x7; } { const v4f l = GDN_L4(59, 2); x59 -= l.x * x8; x59 -= l.y * x9; x59 -= l.z * x10; x59 -= l.w * x11; } { const v4f l = GDN_L4(59, 3); x59 -= l.x * x12; x59 -= l.y * x13; x59 -= l.z * x14; x59 -= l.w * x15; } { const v4f l = GDN_L4(59, 4); x59 -= l.x * x16; x59 -= l.y * x17; x59 -= l.z * x18; x59 -= l.w * x19; } { const v4f l = GDN_L4(59, 5); x59 -= l.x * x20; x59 -= l.y * x21; x59 -= l.z * x22; x59 -= l.w * x23; } { const v4f l = GDN_L4(59, 6); x59 -= l.x * x24; x59 -= l.y * x25; x59 -= l.z * x26; x59 -= l.w * x27; } { const v4f l = GDN_L4(59, 7); x59 -= l.x * x28; x59 -= l.y * x29; x59 -= l.z * x30; x59 -= l.w * x31; } { const v4f l = GDN_L4(59, 8); x59 -= l.x * x32; x59 -= l.y * x33; x59 -= l.z * x34; x59 -= l.w * x35; } { const v4f l = GDN_L4(59, 9); x59 -= l.x * x36; x59 -= l.y * x37; x59 -= l.z * x38; x59 -= l.w * x39; } { const v4f l = GDN_L4(59, 10); x59 -= l.x * x40; x59 -= l.y * x41; x59 -= l.z * x42; x59 -= l.w * x43; } { const v4f l = GDN_L4(59, 11); x59 -= l.x * x44; x59 -= l.y * x45; x59 -= l.z * x46; x59 -= l.w * x47; } { const v4f l = GDN_L4(59, 12); x59 -= l.x * x48; x59 -= l.y * x49; x59 -= l.z * x50; x59 -= l.w * x51; } { const v4f l = GDN_L4(59, 13); x59 -= l.x * x52; x59 -= l.y * x53; x59 -= l.z * x54; x59 -= l.w * x55; } { const v4f l = GDN_L4(59, 14); x59 -= l.x * x56; x59 -= l.y * x57; x59 -= l.z * x58; } __builtin_amdgcn_sched_barrier(0);
        float x60 = GDN_RHS(60); { const v4f l = GDN_L4(60, 0); x60 -= l.x * x0; x60 -= l.y * x1; x60 -= l.z * x2; x60 -= l.w * x3; } { const v4f l = GDN_L4(60, 1); x60 -= l.x * x4; x60 -= l.y * x5; x60 -= l.z * x6; x60 -= l.w * x7; } { const v4f l = GDN_L4(60, 2); x60 -= l.x * x8; x60 -= l.y * x9; x60 -= l.z * x10; x60 -= l.w * x11; } { const v4f l = GDN_L4(60, 3); x60 -= l.x * x12; x60 -= l.y * x13; x60 -= l.z * x14; x60 -= l.w * x15; } { const v4f l = GDN_L4(60, 4); x60 -= l.x * x16; x60 -= l.y * x17; x60 -= l.z * x18; x60 -= l.w * x19; } { const v4f l = GDN_L4(60, 5); x60 -= l.x * x20; x60 -= l.y * x21; x60 -= l.z * x22; x60 -= l.w * x23; } { const v4f l = GDN_L4(60, 6); x60 -= l.x * x24; x60 -= l.y * x25; x60 -= l.z * x26; x60 -= l.w * x27; } { const v4f l = GDN_L4(60, 7); x60 -= l.x * x28; x60 -= l.y * x29; x60 -= l.z * x30; x60 -= l.w * x31; } { const v4f l = GDN_L4(60, 8); x60 -= l.x * x32; x60 -= l.y * x33; x60 -= l.z * x34; x60 -= l.w * x35; } { const v4f l = GDN_L4(60, 9); x60 -= l.x * x36; x60 -= l.y * x37; x60 -= l.z * x38; x60 -= l.w * x39; } { const v4f l = GDN_L4(60, 10); x60 -= l.x * x40; x60 -= l.y * x41; x60 -= l.z * x42; x60 -= l.w * x43; } { const v4f l = GDN_L4(60, 11); x60 -= l.x * x44; x60 -= l.y * x45; x60 -= l.z * x46; x60 -= l.w * x47; } { const v4f l = GDN_L4(60, 12); x60 -= l.x * x48; x60 -= l.y * x49; x60 -= l.z * x50; x60 -= l.w * x51; } { const v4f l = GDN_L4(60, 13); x60 -= l.x * x52; x60 -= l.y * x53; x60 -= l.z * x54; x60 -= l.w * x55; } { const v4f l = GDN_L4(60, 14); x60 -= l.x * x56; x60 -= l.y * x57; x60 -= l.z * x58; x60 -= l.w * x59; } __builtin_amdgcn_sched_barrier(0);
        float x61 = GDN_RHS(61); { const v4f l = GDN_L4(61, 0); x61 -= l.x * x0; x61 -= l.y * x1; x61 -= l.z * x2; x61 -= l.w * x3; } { const v4f l = GDN_L4(61, 1); x61 -= l.x * x4; x61 -= l.y * x5; x61 -= l.z * x6; x61 -= l.w * x7; } { const v4f l = GDN_L4(61, 2); x61 -= l.x * x8; x61 -= l.y * x9; x61 -= l.z * x10; x61 -= l.w * x11; } { const v4f l = GDN_L4(61, 3); x61 -= l.x * x12; x61 -= l.y * x13; x61 -= l.z * x14; x61 -= l.w * x15; } { const v4f l = GDN_L4(61, 4); x61 -= l.x * x16; x61 -= l.y * x17; x61 -= l.z * x18; x61 -= l.w * x19; } { const v4f l = GDN_L4(61, 5); x61 -= l.x * x20; x61 -= l.y * x21; x61 -= l.z * x22; x61 -= l.w * x23; } { const v4f l = GDN_L4(61, 6); x61 -= l.x * x24; x61 -= l.y * x25; x61 -= l.z * x26; x61 -= l.w * x27; } { const v4f l = GDN_L4(61, 7); x61 -= l.x * x28; x61 -= l.y * x29; x61 -= l.z * x30; x61 -= l.w * x31; } { const v4f l = GDN_L4(61, 8); x61 -= l.x * x32; x61 -= l.y * x33; x61 -= l.z * x34; x61 -= l.w * x35; } { const v4f l = GDN_L4(61, 9); x61 -= l.x * x36; x61 -= l.y * x37; x61 -= l.z * x38; x61 -= l.w * x39; } { const v4f l = GDN_L4(61, 10); x61 -= l.x * x40; x61 -= l.y * x41; x61 -= l.z * x42; x61 -= l.w * x43; } { const v4f l = GDN_L4(61, 11); x61 -= l.x * x44; x61 -= l.y * x45; x61 -= l.z * x46; x61 -= l.w * x47; } { const v4f l = GDN_L4(61, 12); x61 -= l.x * x48; x61 -= l.y * x49; x61 -= l.z * x50; x61 -= l.w * x51; } { const v4f l = GDN_L4(61, 13); x61 -= l.x * x52; x61 -= l.y * x53; x61 -= l.z * x54; x61 -= l.w * x55; } { const v4f l = GDN_L4(61, 14); x61 -= l.x * x56; x61 -= l.y * x57; x61 -= l.z * x58; x61 -= l.w * x59; } { const v4f l = GDN_L4(61, 15); x61 -= l.x * x60; } __builtin_amdgcn_sched_barrier(0);
        float x62 = GDN_RHS(62); { const v4f l = GDN_L4(62, 0); x62 -= l.x * x0; x62 -= l.y * x1; x62 -= l.z * x2; x62 -= l.w * x3; } { const v4f l = GDN_L4(62, 1); x62 -= l.x * x4; x62 -= l.y * x5; x62 -= l.z * x6; x62 -= l.w * x7; } { const v4f l = GDN_L4(62, 2); x62 -= l.x * x8; x62 -= l.y * x9; x62 -= l.z * x10; x62 -= l.w * x11; } { const v4f l = GDN_L4(62, 3); x62 -= l.x * x12; x62 -= l.y * x13; x62 -= l.z * x14; x62 -= l.w * x15; } { const v4f l = GDN_L4(62, 4); x62 -= l.x * x16; x62 -= l.y * x17; x62 -= l.z * x18; x62 -= l.w * x19; } { const v4f l = GDN_L4(62, 5); x62 -= l.x * x20; x62 -= l.y * x21; x62 -= l.z * x22; x62 -= l.w * x23; } { const v4f l = GDN_L4(62, 6); x62 -= l.x * x24; x62 -= l.y * x25; x62 -= l.z * x26; x62 -= l.w * x27; } { const v4f l = GDN_L4(62, 7); x62 -= l.x * x28; x62 -= l.y * x29; x62 -= l.z * x30; x62 -= l.w * x31; } { const v4f l = GDN_L4(62, 8); x62 -= l.x * x32; x62 -= l.y * x33; x62 -= l.z * x34; x62 -= l.w * x35; } { const v4f l = GDN_L4(62, 9); x62 -= l.x * x36; x62 -= l.y * x37; x62 -= l.z * x38; x62 -= l.w * x39; } { const v4f l = GDN_L4(62, 10); x62 -= l.x * x40; x62 -= l.y * x41; x62 -= l.z * x42; x62 -= l.w * x43; } { const v4f l = GDN_L4(62, 11); x62 -= l.x * x44; x62 -= l.y * x45; x62 -= l.z * x46; x62 -= l.w * x47; } { const v4f l = GDN_L4(62, 12); x62 -= l.x * x48; x62 -= l.y * x49; x62 -= l.z * x50; x62 -= l.w * x51; } { const v4f l = GDN_L4(62, 13); x62 -= l.x * x52; x62 -= l.y * x53; x62 -= l.z * x54; x62 -= l.w * x55; } { const v4f l = GDN_L4(62, 14); x62 -= l.x * x56; x62 -= l.y * x57; x62 -= l.z * x58; x62 -= l.w * x59; } { const v4f l = GDN_L4(62, 15); x62 -= l.x * x60; x62 -= l.y * x61; } __builtin_amdgcn_sched_barrier(0);
        float x63 = GDN_RHS(63); { const v4f l = GDN_L4(63, 0); x63 -= l.x * x0; x63 -= l.y * x1; x63 -= l.z * x2; x63 -= l.w * x3; } { const v4f l = GDN_L4(63, 1); x63 -= l.x * x4; x63 -= l.y * x5; x63 -= l.z * x6; x63 -= l.w * x7; } { const v4f l = GDN_L4(63, 2); x63 -= l.x * x8; x63 -= l.y * x9; x63 -= l.z * x10; x63 -= l.w * x11; } { const v4f l = GDN_L4(63, 3); x63 -= l.x * x12; x63 -= l.y * x13; x63 -= l.z * x14; x63 -= l.w * x15; } { const v4f l = GDN_L4(63, 4); x63 -= l.x * x16; x63 -= l.y * x17; x63 -= l.z * x18; x63 -= l.w * x19; } { const v4f l = GDN_L4(63, 5); x63 -= l.x * x20; x63 -= l.y * x21; x63 -= l.z * x22; x63 -= l.w * x23; } { const v4f l = GDN_L4(63, 6); x63 -= l.x * x24; x63 -= l.y * x25; x63 -= l.z * x26; x63 -= l.w * x27; } { const v4f l = GDN_L4(63, 7); x63 -= l.x * x28; x63 -= l.y * x29; x63 -= l.z * x30; x63 -= l.w * x31; } { const v4f l = GDN_L4(63, 8); x63 -= l.x * x32; x63 -= l.y * x33; x63 -= l.z * x34; x63 -= l.w * x35; } { const v4f l = GDN_L4(63, 9); x63 -= l.x * x36; x63 -= l.y * x37; x63 -= l.z * x38; x63 -= l.w * x39; } { const v4f l = GDN_L4(63, 10); x63 -= l.x * x40; x63 -= l.y * x41; x63 -= l.z * x42; x63 -= l.w * x43; } { const v4f l = GDN_L4(63, 11); x63 -= l.x * x44; x63 -= l.y * x45; x63 -= l.z * x46; x63 -= l.w * x47; } { const v4f l = GDN_L4(63, 12); x63 -= l.x * x48; x63 -= l.y * x49; x63 -= l.z * x50; x63 -= l.w * x51; } { const v4f l = GDN_L4(63, 13); x63 -= l.x * x52; x63 -= l.y * x53; x63 -= l.z * x54; x63 -= l.w * x55; } { const v4f l = GDN_L4(63, 14); x63 -= l.x * x56; x63 -= l.y * x57; x63 -= l.z * x58; x63 -= l.w * x59; } { const v4f l = GDN_L4(63, 15); x63 -= l.x * x60; x63 -= l.y * x61; x63 -= l.z * x62; } __builtin_amdgcn_sched_barrier(0);
        if (c < 128) { GU[0 * 128 + c] = x0; GU[1 * 128 + c] = x1; GU[2 * 128 + c] = x2; GU[3 * 128 + c] = x3; GU[4 * 128 + c] = x4; GU[5 * 128 + c] = x5; GU[6 * 128 + c] = x6; GU[7 * 128 + c] = x7; GU[8 * 128 + c] = x8; GU[9 * 128 + c] = x9; GU[10 * 128 + c] = x10; GU[11 * 128 + c] = x11; GU[12 * 128 + c] = x12; GU[13 * 128 + c] = x13; GU[14 * 128 + c] = x14; GU[15 * 128 + c] = x15; GU[16 * 128 + c] = x16; GU[17 * 128 + c] = x17; GU[18 * 128 + c] = x18; GU[19 * 128 + c] = x19; GU[20 * 128 + c] = x20; GU[21 * 128 + c] = x21; GU[22 * 128 + c] = x22; GU[23 * 128 + c] = x23; GU[24 * 128 + c] = x24; GU[25 * 128 + c] = x25; GU[26 * 128 + c] = x26; GU[27 * 128 + c] = x27; GU[28 * 128 + c] = x28; GU[29 * 128 + c] = x29; GU[30 * 128 + c] = x30; GU[31 * 128 + c] = x31; GU[32 * 128 + c] = x32; GU[33 * 128 + c] = x33; GU[34 * 128 + c] = x34; GU[35 * 128 + c] = x35; GU[36 * 128 + c] = x36; GU[37 * 128 + c] = x37; GU[38 * 128 + c] = x38; GU[39 * 128 + c] = x39; GU[40 * 128 + c] = x40; GU[41 * 128 + c] = x41; GU[42 * 128 + c] = x42; GU[43 * 128 + c] = x43; GU[44 * 128 + c] = x44; GU[45 * 128 + c] = x45; GU[46 * 128 + c] = x46; GU[47 * 128 + c] = x47; GU[48 * 128 + c] = x48; GU[49 * 128 + c] = x49; GU[50 * 128 + c] = x50; GU[51 * 128 + c] = x51; GU[52 * 128 + c] = x52; GU[53 * 128 + c] = x53; GU[54 * 128 + c] = x54; GU[55 * 128 + c] = x55; GU[56 * 128 + c] = x56; GU[57 * 128 + c] = x57; GU[58 * 128 + c] = x58; GU[59 * 128 + c] = x59; GU[60 * 128 + c] = x60; GU[61 * 128 + c] = x61; GU[62 * 128 + c] = x62; GU[63 * 128 + c] = x63; }
        else { GNW[0 * 128 + (c - 128)] = (bf16)f2bf(-x0); GNW[1 * 128 + (c - 128)] = (bf16)f2bf(-x1); GNW[2 * 128 + (c - 128)] = (bf16)f2bf(-x2); GNW[3 * 128 + (c - 128)] = (bf16)f2bf(-x3); GNW[4 * 128 + (c - 128)] = (bf16)f2bf(-x4); GNW[5 * 128 + (c - 128)] = (bf16)f2bf(-x5); GNW[6 * 128 + (c - 128)] = (bf16)f2bf(-x6); GNW[7 * 128 + (c - 128)] = (bf16)f2bf(-x7); GNW[8 * 128 + (c - 128)] = (bf16)f2bf(-x8); GNW[9 * 128 + (c - 128)] = (bf16)f2bf(-x9); GNW[10 * 128 + (c - 128)] = (bf16)f2bf(-x10); GNW[11 * 128 + (c - 128)] = (bf16)f2bf(-x11); GNW[12 * 128 + (c - 128)] = (bf16)f2bf(-x12); GNW[13 * 128 + (c - 128)] = (bf16)f2bf(-x13); GNW[14 * 128 + (c - 128)] = (bf16)f2bf(-x14); GNW[15 * 128 + (c - 128)] = (bf16)f2bf(-x15); GNW[16 * 128 + (c - 128)] = (bf16)f2bf(-x16); GNW[17 * 128 + (c - 128)] = (bf16)f2bf(-x17); GNW[18 * 128 + (c - 128)] = (bf16)f2bf(-x18); GNW[19 * 128 + (c - 128)] = (bf16)f2bf(-x19); GNW[20 * 128 + (c - 128)] = (bf16)f2bf(-x20); GNW[21 * 128 + (c - 128)] = (bf16)f2bf(-x21); GNW[22 * 128 + (c - 128)] = (bf16)f2bf(-x22); GNW[23 * 128 + (c - 128)] = (bf16)f2bf(-x23); GNW[24 * 128 + (c - 128)] = (bf16)f2bf(-x24); GNW[25 * 128 + (c - 128)] = (bf16)f2bf(-x25); GNW[26 * 128 + (c - 128)] = (bf16)f2bf(-x26); GNW[27 * 128 + (c - 128)] = (bf16)f2bf(-x27); GNW[28 * 128 + (c - 128)] = (bf16)f2bf(-x28); GNW[29 * 128 + (c - 128)] = (bf16)f2bf(-x29); GNW[30 * 128 + (c - 128)] = (bf16)f2bf(-x30); GNW[31 * 128 + (c - 128)] = (bf16)f2bf(-x31); GNW[32 * 128 + (c - 128)] = (bf16)f2bf(-x32); GNW[33 * 128 + (c - 128)] = (bf16)f2bf(-x33); GNW[34 * 128 + (c - 128)] = (bf16)f2bf(-x34); GNW[35 * 128 + (c - 128)] = (bf16)f2bf(-x35); GNW[36 * 128 + (c - 128)] = (bf16)f2bf(-x36); GNW[37 * 128 + (c - 128)] = (bf16)f2bf(-x37); GNW[38 * 128 + (c - 128)] = (bf16)f2bf(-x38); GNW[39 * 128 + (c - 128)] = (bf16)f2bf(-x39); GNW[40 * 128 + (c - 128)] = (bf16)f2bf(-x40); GNW[41 * 128 + (c - 128)] = (bf16)f2bf(-x41); GNW[42 * 128 + (c - 128)] = (bf16)f2bf(-x42); GNW[43 * 128 + (c - 128)] = (bf16)f2bf(-x43); GNW[44 * 128 + (c - 128)] = (bf16)f2bf(-x44); GNW[45 * 128 + (c - 128)] = (bf16)f2bf(-x45); GNW[46 * 128 + (c - 128)] = (bf16)f2bf(-x46); GNW[47 * 128 + (c - 128)] = (bf16)f2bf(-x47); GNW[48 * 128 + (c - 128)] = (bf16)f2bf(-x48); GNW[49 * 128 + (c - 128)] = (bf16)f2bf(-x49); GNW[50 * 128 + (c - 128)] = (bf16)f2bf(-x50); GNW[51 * 128 + (c - 128)] = (bf16)f2bf(-x51); GNW[52 * 128 + (c - 128)] = (bf16)f2bf(-x52); GNW[53 * 128 + (c - 128)] = (bf16)f2bf(-x53); GNW[54 * 128 + (c - 128)] = (bf16)f2bf(-x54); GNW[55 * 128 + (c - 128)] = (bf16)f2bf(-x55); GNW[56 * 128 + (c - 128)] = (bf16)f2bf(-x56); GNW[57 * 128 + (c - 128)] = (bf16)f2bf(-x57); GNW[58 * 128 + (c - 128)] = (bf16)f2bf(-x58); GNW[59 * 128 + (c - 128)] = (bf16)f2bf(-x59); GNW[60 * 128 + (c - 128)] = (bf16)f2bf(-x60); GNW[61 * 128 + (c - 128)] = (bf16)f2bf(-x61); GNW[62 * 128 + (c - 128)] = (bf16)f2bf(-x62); GNW[63 * 128 + (c - 128)] = (bf16)f2bf(-x63); }
#undef GDN_RHS
#undef GDN_L4
    } else {
        const int t2 = tid - 256; const float gl = gcs[63];
        { const int i = t2 >> 2, d0 = (t2 & 3) * 32; const float e = __expf(gcs[i]);
#pragma unroll
          for (int x8 = 0; x8 < 4; ++x8) { const v4f a = *(const LAS v4f*)(qs + i * QP + d0 + 8 * x8), b = *(const LAS v4f*)(qs + i * QP + d0 + 8 * x8 + 4);
              v4u w; w.x = pk2(a.x * e, a.y * e); w.y = pk2(a.z * e, a.w * e); w.z = pk2(b.x * e, b.y * e); w.w = pk2(b.z * e, b.w * e); *(v4u*)(GQG + i * 128 + d0 + 8 * x8) = w; } }
        { const int d = t2 >> 1, j0 = (t2 & 1) * 32;
#pragma unroll
          for (int x8 = 0; x8 < 4; ++x8) { float o[8];
#pragma unroll
              for (int x = 0; x < 8; ++x) { const int j = j0 + 8 * x8 + x; o[x] = ks[j * QP + d] * __expf(gl - gcs[j]); }
              v4u w; w.x = pk2(o[0], o[1]); w.y = pk2(o[2], o[3]); w.z = pk2(o[4], o[5]); w.w = pk2(o[6], o[7]); *(v4u*)(GKT + d * 64 + j0 + 8 * x8) = w; } }
        if (t2 == 0) GDL[item] = __expf(gl);
    }
    __syncthreads();
}
struct GdnFrags { bf16x8_t nw[4], qg[4], at[2], kt[2][2]; float u[4]; float dl; };
__device__ __forceinline__ void gdn_load(GdnFrags& F, const Params& p, int item, int off128, int off64, int offk, int offu) {
    const bf16* GNW = (const bf16*)(p.ws + WS_GNW) + (size_t)item * 8192; const bf16* GQG = (const bf16*)(p.ws + WS_GQG) + (size_t)item * 8192;
    const bf16* GAT = (const bf16*)(p.ws + WS_GAT) + (size_t)item * 4096; const bf16* GKT = (const bf16*)(p.ws + WS_GKT) + (size_t)item * 8192; const float* GU = (const float*)(p.ws + WS_GU) + (size_t)item * 8192;
#pragma unroll
    for (int ks = 0; ks < 4; ++ks) { F.nw[ks] = *(const bf16x8_t*)(GNW + off128 + 32 * ks); F.qg[ks] = *(const bf16x8_t*)(GQG + off128 + 32 * ks); }
#pragma unroll
    for (int ks = 0; ks < 2; ++ks) { F.at[ks] = *(const bf16x8_t*)(GAT + off64 + 32 * ks); F.kt[0][ks] = *(const bf16x8_t*)(GKT + offk + 32 * ks); F.kt[1][ks] = *(const bf16x8_t*)(GKT + offk + 1024 + 32 * ks); }
#pragma unroll
    for (int r = 0; r < 4; ++r) F.u[r] = GU[offu + r * 128];
    F.dl = ((const float*)(p.ws + WS_GDL))[item];
}
constexpr int STP = 136, VNP = 72;
__device__ __forceinline__ void gdn_seq(const Params& p, LAS unsigned char* lds, int wgi, int wave, int lane) {
    const int u = wgi * 2 + (wave >> 2), wi = wave & 3, h = u >> 3, sl = u & 7, g = lane >> 4, c = lane & 15;
    LAS unsigned short* ST = (LAS unsigned short*)(lds + (wave >> 2) * 12288);
    LAS unsigned short* VNT = ST + 2 * 16 * STP;
    float* GO = (float*)(p.ws + WS_GO);
    const int off128 = (16 * wi + c) * 128 + 8 * g, off64 = (16 * wi + c) * 64 + 8 * g, offk = (32 * wi + c) * 64 + 8 * g, offu = (16 * wi + 4 * g) * 128 + 16 * sl + c;
#pragma unroll
    for (int mt = 0; mt < 2; ++mt) *(LAS v2u*)(ST + c * STP + 16 * (2 * wi + mt) + 4 * g) = (v2u){0u, 0u};
    pg8::f32x4 Sacc[2] = {{0.f, 0.f, 0.f, 0.f}, {0.f, 0.f, 0.f, 0.f}};
    __syncthreads();
    GdnFrags F0, F1;
    gdn_load(F0, p, h, off128, off64, offk, offu);
#define GDN_STEP(F, n_) do { const int cur = (n_) & 1; bf16x8_t sf[4]; \
        _Pragma("unroll") for (int ks = 0; ks < 4; ++ks) sf[ks] = *(const LAS bf16x8_t*)(ST + cur * 16 * STP + c * STP + 32 * ks + 8 * g); \
        pg8::f32x4 vn = {F.u[0], F.u[1], F.u[2], F.u[3]}; \
        _Pragma("unroll") for (int ks = 0; ks < 4; ++ks) vn = __builtin_amdgcn_mfma_f32_16x16x32_bf16(F.nw[ks], sf[ks], vn, 0, 0, 0); \
        { v2u w; w.x = pk2(vn[0], vn[1]); w.y = pk2(vn[2], vn[3]); *(LAS v2u*)(VNT + c * VNP + 16 * wi + 4 * g) = w; } \
        LDS_BAR(); \
        const bf16x8_t v0 = *(const LAS bf16x8_t*)(VNT + c * VNP + 8 * g), v1 = *(const LAS bf16x8_t*)(VNT + c * VNP + 32 + 8 * g); \
        pg8::f32x4 o = {0.f, 0.f, 0.f, 0.f}; \
        _Pragma("unroll") for (int ks = 0; ks < 4; ++ks) o = __builtin_amdgcn_mfma_f32_16x16x32_bf16(F.qg[ks], sf[ks], o, 0, 0, 0); \
        o = __builtin_amdgcn_mfma_f32_16x16x32_bf16(F.at[0], v0, o, 0, 0, 0); o = __builtin_amdgcn_mfma_f32_16x16x32_bf16(F.at[1], v1, o, 0, 0, 0); \
        { const size_t tb = (size_t)(n_) * 64 + 16 * wi + 4 * g; _Pragma("unroll") for (int r = 0; r < 4; ++r) GO[(tb + r) * BW + h * 128 + 16 * sl + c] = o[r]; } \
        _Pragma("unroll") for (int mt = 0; mt < 2; ++mt) { Sacc[mt] = Sacc[mt] * F.dl; \
            Sacc[mt] = __builtin_amdgcn_mfma_f32_16x16x32_bf16(F.kt[mt][0], v0, Sacc[mt], 0, 0, 0); Sacc[mt] = __builtin_amdgcn_mfma_f32_16x16x32_bf16(F.kt[mt][1], v1, Sacc[mt], 0, 0, 0); \
            v2u w; w.x = pk2(Sacc[mt][0], Sacc[mt][1]); w.y = pk2(Sacc[mt][2], Sacc[mt][3]); *(LAS v2u*)(ST + (cur ^ 1) * 16 * STP + c * STP + 16 * (2 * wi + mt) + 4 * g) = w; } \
        LDS_BAR(); } while (0)
    for (int n = 0; n < T / 64; n += 2) {
        gdn_load(F1, p, (n + 1) * 4 + h, off128, off64, offk, offu);
        GDN_STEP(F0, n);
        gdn_load(F0, p, ((n + 2 < T / 64) ? n + 2 : n) * 4 + h, off128, off64, offk, offu);
        GDN_STEP(F1, n + 1);
    }
#undef GDN_STEP
}

constexpr int SEQ_UOFF = 132096;
constexpr int GI_NW = 0, GI_QG = 8704, GI_AT = 17408, GI_KT = 22016, GI_SZ = 31232;
struct GdnStage { v4u r[7]; float u[4]; float dl; };
__device__ __forceinline__ void gdn_stage_load(GdnStage& Sg, const Params& p, int item, int tid, int offu) {
    const bf16* GNW = (const bf16*)(p.ws + WS_GNW) + (size_t)item * 8192; const bf16* GQG = (const bf16*)(p.ws + WS_GQG) + (size_t)item * 8192;
    const bf16* GAT = (const bf16*)(p.ws + WS_GAT) + (size_t)item * 4096; const bf16* GKT = (const bf16*)(p.ws + WS_GKT) + (size_t)item * 8192; const float* GU = (const float*)(p.ws + WS_GU) + (size_t)item * 8192;
    Sg.r[0] = *(const v4u*)(GNW + 8 * tid); Sg.r[1] = *(const v4u*)(GNW + 8 * (tid + 512)); Sg.r[2] = *(const v4u*)(GQG + 8 * tid); Sg.r[3] = *(const v4u*)(GQG + 8 * (tid + 512));
    Sg.r[4] = *(const v4u*)(GAT + 8 * tid); Sg.r[5] = *(const v4u*)(GKT + 8 * tid); Sg.r[6] = *(const v4u*)(GKT + 8 * (tid + 512));
#pragma unroll
    for (int r = 0; r < 4; ++r) Sg.u[r] = GU[offu + r * 128];
    Sg.dl = ((const float*)(p.ws + WS_GDL))[item];
}
__device__ __forceinline__ void gdn_stage_write(const GdnStage& Sg, LAS unsigned short* img, int tid) {
    { const int p0 = tid, p1 = tid + 512;
      *(LAS v4u*)(img + GI_NW + (p0 >> 4) * 136 + 8 * (p0 & 15)) = Sg.r[0]; *(LAS v4u*)(img + GI_NW + (p1 >> 4) * 136 + 8 * (p1 & 15)) = Sg.r[1];
      *(LAS v4u*)(img + GI_QG + (p0 >> 4) * 136 + 8 * (p0 & 15)) = Sg.r[2]; *(LAS v4u*)(img + GI_QG + (p1 >> 4) * 136 + 8 * (p1 & 15)) = Sg.r[3];
      *(LAS v4u*)(img + GI_AT + (p0 >> 3) * 72 + 8 * (p0 & 7)) = Sg.r[4];
      *(LAS v4u*)(img + GI_KT + (p0 >> 3) * 72 + 8 * (p0 & 7)) = Sg.r[5]; *(LAS v4u*)(img + GI_KT + (p1 >> 3) * 72 + 8 * (p1 & 7)) = Sg.r[6]; }
}
__device__ __forceinline__ void gdn_seq2(const Params& p, LAS unsigned char* lds, int wgi, int tid, int wave, int lane) {
    const int h = wgi >> 2, sl = 2 * (wgi & 3) + (wave >> 2), wi = wave & 3, g = lane >> 4, c = lane & 15;
    LAS unsigned short* IMG = (LAS unsigned short*)lds;
    LAS unsigned short* ST = (LAS unsigned short*)(lds + SEQ_UOFF + (wave >> 2) * 12288);
    LAS unsigned short* VNT = ST + 2 * 16 * STP;
    float* GO = (float*)(p.ws + WS_GO);
    const int offu = (16 * wi + 4 * g) * 128 + 16 * sl + c;
#pragma unroll
    for (int mt = 0; mt < 2; ++mt) *(LAS v2u*)(ST + c * STP + 16 * (2 * wi + mt) + 4 * g) = (v2u){0u, 0u};
    pg8::f32x4 Sacc[2] = {{0.f, 0.f, 0.f, 0.f}, {0.f, 0.f, 0.f, 0.f}};
    GdnStage A, B;
    gdn_stage_load(A, p, h, tid, offu); gdn_stage_write(A, IMG, tid);
    gdn_stage_load(B, p, 4 + h, tid, offu);
    LDS_BAR();
    constexpr int NCH = T / 64;
#define GDN_STEP2(X, Y, n_) do { const int cur = (n_) & 1; const LAS unsigned short* im = IMG + cur * GI_SZ; bf16x8_t sf[4]; \
        _Pragma("unroll") for (int ks = 0; ks < 4; ++ks) sf[ks] = *(const LAS bf16x8_t*)(ST + cur * 16 * STP + c * STP + 32 * ks + 8 * g); \
        pg8::f32x4 vn = {X.u[0], X.u[1], X.u[2], X.u[3]}; const float dl = X.dl; \
        _Pragma("unroll") for (int ks = 0; ks < 4; ++ks) vn = __builtin_amdgcn_mfma_f32_16x16x32_bf16(*(const LAS bf16x8_t*)(im + GI_NW + (16 * wi + c) * 136 + 32 * ks + 8 * g), sf[ks], vn, 0, 0, 0); \
        { v2u w; w.x = pk2(vn[0], vn[1]); w.y = pk2(vn[2], vn[3]); *(LAS v2u*)(VNT + c * VNP + 16 * wi + 4 * g) = w; } \
        pg8::f32x4 o = {0.f, 0.f, 0.f, 0.f}; \
        _Pragma("unroll") for (int ks = 0; ks < 4; ++ks) o = __builtin_amdgcn_mfma_f32_16x16x32_bf16(*(const LAS bf16x8_t*)(im + GI_QG + (16 * wi + c) * 136 + 32 * ks + 8 * g), sf[ks], o, 0, 0, 0); \
        LDS_BAR(); \
        gdn_stage_load(X, p, (((n_) + 2 < NCH) ? (n_) + 2 : (n_)) * 4 + h, tid, offu); \
        const bf16x8_t v0 = *(const LAS bf16x8_t*)(VNT + c * VNP + 8 * g), v1 = *(const LAS bf16x8_t*)(VNT + c * VNP + 32 + 8 * g); \
        o = __builtin_amdgcn_mfma_f32_16x16x32_bf16(*(const LAS bf16x8_t*)(im + GI_AT + (16 * wi + c) * 72 + 8 * g), v0, o, 0, 0, 0); \
        o = __builtin_amdgcn_mfma_f32_16x16x32_bf16(*(const LAS bf16x8_t*)(im + GI_AT + (16 * wi + c) * 72 + 32 + 8 * g), v1, o, 0, 0, 0); \
        { const size_t tb = (size_t)(n_) * 64 + 16 * wi + 4 * g; _Pragma("unroll") for (int r = 0; r < 4; ++r) GO[(tb + r) * BW + h * 128 + 16 * sl + c] = o[r]; } \
        _Pragma("unroll") for (int mt = 0; mt < 2; ++mt) { Sacc[mt] = Sacc[mt] * dl; \
            Sacc[mt] = __builtin_amdgcn_mfma_f32_16x16x32_bf16(*(const LAS bf16x8_t*)(im + GI_KT + (16 * (2 * wi + mt) + c) * 72 + 8 * g), v0, Sacc[mt], 0, 0, 0); \
            Sacc[mt] = __builtin_amdgcn_mfma_f32_16x16x32_bf16(*(const LAS bf16x8_t*)(im + GI_KT + (16 * (2 * wi + mt) + c) * 72 + 32 + 8 * g), v1, Sacc[mt], 0, 0, 0); \
            v2u w; w.x = pk2(Sacc[mt][0], Sacc[mt][1]); w.y = pk2(Sacc[mt][2], Sacc[mt][3]); *(LAS v2u*)(ST + (cur ^ 1) * 16 * STP + c * STP + 16 * (2 * wi + mt) + 4 * g) = w; } \
        gdn_stage_write(Y, IMG + (cur ^ 1) * GI_SZ, tid); \
        LDS_BAR(); } while (0)
    for (int n = 0; n < NCH; n += 2) { GDN_STEP2(A, B, n); GDN_STEP2(B, A, n + 1); }
#undef GDN_STEP2
}
constexpr int MI_Q = 0, MI_S = 4608, MI_K = 9216, MI_SZ = 13824;
struct MlStage { v4u r[3]; bf16x8_t vt[2]; float fl; };
__device__ __forceinline__ void ml_stage_load(MlStage& Sg, const Params& p, int item, int tid, int offV) {
    const bf16* MQ = (const bf16*)(p.ws + WS_MQ) + (size_t)item * 4096; const bf16* MS = (const bf16*)(p.ws + WS_MS) + (size_t)item * 4096; const bf16* MK = (const bf16*)(p.ws + WS_MK) + (size_t)item * 4096;
    const bf16* MV = (const bf16*)(p.ws + WS_MV) + (size_t)item * 9216;
    Sg.r[0] = *(const v4u*)(MQ + 8 * tid); Sg.r[1] = *(const v4u*)(MS + 8 * tid); Sg.r[2] = *(const v4u*)(MK + 8 * tid);
    Sg.vt[0] = *(const bf16x8_t*)(MV + offV); Sg.vt[1] = *(const bf16x8_t*)(MV + offV + 32);
    Sg.fl = ((const float*)(p.ws + WS_MFL))[item];
}
__device__ __forceinline__ void ml_stage_write(const MlStage& Sg, LAS unsigned short* img, int tid) {
    const int o = (tid >> 3) * 72 + 8 * (tid & 7);
    *(LAS v4u*)(img + MI_Q + o) = Sg.r[0]; *(LAS v4u*)(img + MI_S + o) = Sg.r[1]; *(LAS v4u*)(img + MI_K + o) = Sg.r[2];
}
__device__ __forceinline__ void ml_seq2(const Params& p, LAS unsigned char* lds, int wgi, int tid, int wave, int lane) {
    const int h = wgi / 5, sl0 = 2 * (wgi % 5) + (wave >> 2), wi = wave & 3, g = lane >> 4, c = lane & 15;
    const bool real = sl0 < 9; const int sl = real ? sl0 : 8;
    LAS unsigned short* IMG = (LAS unsigned short*)lds;
    LAS unsigned short* CT = (LAS unsigned short*)(lds + SEQ_UOFF + (wave >> 2) * 8192);
    float* HO = (float*)(p.ws + WS_HO); float* HDEN = (float*)(p.ws + WS_HDEN);
    const int offV = (16 * sl + c) * 64 + 8 * g;
    *(LAS v2u*)(CT + c * 72 + 16 * wi + 4 * g) = (v2u){0u, 0u};
    pg8::f32x4 Cacc = {0.f, 0.f, 0.f, 0.f};
    MlStage A, B;
    ml_stage_load(A, p, h, tid, offV); ml_stage_write(A, IMG, tid);
    ml_stage_load(B, p, 4 + h, tid, offV);
    LDS_BAR();
    constexpr int NCH = T / 64;
#define ML_STEP2(X, Y, n_) do { const int cur = (n_) & 1; const LAS unsigned short* im = IMG + cur * MI_SZ; const int ro = (16 * wi + c) * 72 + 8 * g; \
        const bf16x8_t c0 = *(const LAS bf16x8_t*)(CT + cur * 16 * 72 + c * 72 + 8 * g), c1 = *(const LAS bf16x8_t*)(CT + cur * 16 * 72 + c * 72 + 32 + 8 * g); \
        const bf16x8_t vt0 = X.vt[0], vt1 = X.vt[1]; const float fl = X.fl; \
        pg8::f32x4 num = {0.f, 0.f, 0.f, 0.f}; \
        num = __builtin_amdgcn_mfma_f32_16x16x32_bf16(*(const LAS bf16x8_t*)(im + MI_Q + ro), c0, num, 0, 0, 0); num = __builtin_amdgcn_mfma_f32_16x16x32_bf16(*(const LAS bf16x8_t*)(im + MI_Q + ro + 32), c1, num, 0, 0, 0); \
        num = __builtin_amdgcn_mfma_f32_16x16x32_bf16(*(const LAS bf16x8_t*)(im + MI_S + ro), vt0, num, 0, 0, 0); num = __builtin_amdgcn_mfma_f32_16x16x32_bf16(*(const LAS bf16x8_t*)(im + MI_S + ro + 32), vt1, num, 0, 0, 0); \
        Cacc = Cacc * fl; \
        Cacc = __builtin_amdgcn_mfma_f32_16x16x32_bf16(*(const LAS bf16x8_t*)(im + MI_K + ro), vt0, Cacc, 0, 0, 0); Cacc = __builtin_amdgcn_mfma_f32_16x16x32_bf16(*(const LAS bf16x8_t*)(im + MI_K + ro + 32), vt1, Cacc, 0, 0, 0); \
        ml_stage_load(X, p, (((n_) + 2 < NCH) ? (n_) + 2 : (n_)) * 4 + h, tid, offV); \
        { v2u w; w.x = pk2(Cacc[0], Cacc[1]); w.y = pk2(Cacc[2], Cacc[3]); *(LAS v2u*)(CT + (cur ^ 1) * 16 * 72 + c * 72 + 16 * wi + 4 * g) = w; } \
        { const size_t tb = (size_t)(n_) * 64 + 16 * wi + 4 * g; \
          if (sl < 8) { _Pragma("unroll") for (int r = 0; r < 4; ++r) HO[(tb + r) * BW + h * 128 + 16 * sl + c] = num[r]; } \
          else if (c == 0 && real) { _Pragma("unroll") for (int r = 0; r < 4; ++r) HDEN[(tb + r) * 4 + h] = num[r]; } } \
        ml_stage_write(Y, IMG + (cur ^ 1) * MI_SZ, tid); \
        LDS_BAR(); } while (0)
    for (int n = 0; n < NCH; n += 2) { ML_STEP2(A, B, n); ML_STEP2(B, A, n + 1); }
#undef ML_STEP2
}

__device__ __forceinline__ void mixer_gmlp_item(const Params& p, int l, LAS unsigned char* lds, int item, int tid, int wave, int lane) {
    const int chunk = item >> 2, g = item & 3; const size_t tok0 = (size_t)chunk * 128;
    const bf16* Z = (const bf16*)(p.ws + WS_Z); bf16* BR1 = (bf16*)(p.ws + WS_BR) + (size_t)1 * T * BW;
    const float* ng = p.in[I_GMNG] + l * BW; const float* nb = p.in[I_GMNB] + l * BW;
    const float* wsp = p.in[I_GMWS] + ((size_t)(l * 4 + g) * 128) * 128; const float* bsp = p.in[I_GMBS] + (l * 4 + g) * 128;
    LAS float* vn = (LAS float*)lds;
    for (int r = 0; r < 16; ++r) { const int tk = wave * 16 + r;
        const v4u raw = *(const v4u*)(Z + (tok0 + tk) * ZC + ZC_GMV + 8 * lane); float x[8]; unpack8(raw, x); float s = 0.f;
#pragma unroll
        for (int i = 0; i < 8; ++i) { x[i] = gelu_tanh(x[i]); s += x[i]; }
        const float mean = wave_sum(s) * (1.f / 512.f); float ss = 0.f;
#pragma unroll
        for (int i = 0; i < 8; ++i) { x[i] -= mean; ss += x[i] * x[i]; }
        const float rstd = rsqrtf(wave_sum(ss) * (1.f / 512.f) + LN_EPS);
        if ((lane >> 4) == g) { const int cl = 8 * (lane & 15);
#pragma unroll
            for (int i = 0; i < 8; ++i) vn[tk * 128 + cl + i] = x[i] * rstd * ng[8 * lane + i] + nb[8 * lane + i]; }
    }
    __syncthreads();
    const int t = tid >> 2, cq = tid & 3; float acc[32];
#pragma unroll
    for (int i = 0; i < 32; ++i) acc[i] = 0.f;
    const float* wrow = wsp + (size_t)t * 128;
    for (int s = 0; s <= t; ++s) { const float w = wrow[s]; const LAS float* row = vn + s * 128 + cq * 32;
#pragma unroll
        for (int i4 = 0; i4 < 8; ++i4) { const v4f a = *(const LAS v4f*)(row + 4 * i4); acc[4 * i4] += w * a.x; acc[4 * i4 + 1] += w * a.y; acc[4 * i4 + 2] += w * a.z; acc[4 * i4 + 3] += w * a.w; } }
    const float bias = bsp[t];
#pragma unroll
    for (int i8 = 0; i8 < 4; ++i8) { const v4u raw = *(const v4u*)(Z + (tok0 + t) * ZC + ZC_GMU + g * 128 + cq * 32 + 8 * i8); float u[8]; unpack8(raw, u); float o[8];
#pragma unroll
        for (int i = 0; i < 8; ++i) o[i] = gelu_tanh(u[i]) * (acc[8 * i8 + i] + bias);
        v4u w; w.x = pk2(o[0], o[1]); w.y = pk2(o[2], o[3]); w.z = pk2(o[4], o[5]); w.w = pk2(o[6], o[7]);
        *(v4u*)(BR1 + (tok0 + t) * BW + g * 128 + cq * 32 + 8 * i8) = w; }
    __syncthreads();
}

__device__ __forceinline__ void vt_item(const Params& p, LAS unsigned char* lds, int item, int tid) {
    const int h = item & 3, n = item >> 2; const size_t t0 = (size_t)n * 64;
    const bf16* Z = (const bf16*)(p.ws + WS_Z); bf16* VT = (bf16*)(p.ws + WS_VT);
    LAS unsigned short* vs = (LAS unsigned short*)lds;
#pragma unroll
    for (int r = 0; r < 2; ++r) { const int idx = tid + 512 * r, tk = idx >> 4, c8 = idx & 15;
        *(LAS v4u*)(vs + tk * 136 + 8 * c8) = *(const v4u*)(Z + (t0 + tk) * ZC + ZC_SBV + h * 128 + 8 * c8); }
    __syncthreads();
    { const int d = tid >> 2, jq = tid & 3; unsigned w[8];
#pragma unroll
      for (int x = 0; x < 8; ++x) w[x] = (unsigned)vs[(16 * jq + 2 * x) * 136 + d] | ((unsigned)vs[(16 * jq + 2 * x + 1) * 136 + d] << 16);
      bf16* dst = VT + ((size_t)h * 128 + d) * T + t0 + 16 * jq;
      *(v4u*)dst = (v4u){w[0], w[1], w[2], w[3]}; *(v4u*)(dst + 8) = (v4u){w[4], w[5], w[6], w[7]}; }
    __syncthreads();
}
constexpr int KTP = 136, VTP = 72;
__device__ __forceinline__ void sb_unit(const Params& p, LAS unsigned char* lds, int unit, int tid, int wave, int lane) {
    const int h = unit >> 6, q0 = (unit & 63) * 128, g = lane >> 4, c = lane & 15; const int qrow = q0 + 16 * wave + c;
    const bf16* Z = (const bf16*)(p.ws + WS_Z); const bf16* VT = (const bf16*)(p.ws + WS_VT) + (size_t)h * 128 * T; bf16* BR0 = (bf16*)(p.ws + WS_BR);
    LAS unsigned short* Kt = (LAS unsigned short*)lds;
    LAS unsigned short* Vt = Kt + 2 * 64 * KTP;
    LAS int* flags = (LAS int*)(Vt + 2 * 128 * VTP);
    bf16x8_t qf[4];
#pragma unroll
    for (int ks = 0; ks < 4; ++ks) qf[ks] = *(const bf16x8_t*)(Z + (size_t)qrow * ZC + ZC_SBQ + h * 128 + 32 * ks + 8 * g);
    pg8::f32x4 acc[8];
#pragma unroll
    for (int dt = 0; dt < 8; ++dt) acc[dt] = (pg8::f32x4){0.f, 0.f, 0.f, 0.f};
    float racc = 0.f;
    v4u kr[2], vr[2];
    const int jt = (q0 >> 6) + 1;
#define SB_GLOAD(j_) do { _Pragma("unroll") for (int r = 0; r < 2; ++r) { const int idx = tid + 512 * r; \
        kr[r] = *(const v4u*)(Z + (size_t)(64 * (j_) + (idx >> 4)) * ZC + ZC_SBK + h * 128 + 8 * (idx & 15)); \
        vr[r] = *(const v4u*)(VT + (size_t)(idx >> 3) * T + 64 * (j_) + 8 * (idx & 7)); } } while (0)
#define SB_LWRITE(b_) do { _Pragma("unroll") for (int r = 0; r < 2; ++r) { const int idx = tid + 512 * r; \
        *(LAS v4u*)(Kt + (b_) * 64 * KTP + (idx >> 4) * KTP + 8 * (idx & 15)) = kr[r]; *(LAS v4u*)(Vt + (b_) * 128 * VTP + (idx >> 3) * VTP + 8 * (idx & 7)) = vr[r]; } } while (0)
    LDS_BAR();
    SB_GLOAD(jt); SB_LWRITE(0);
    LDS_BAR();
    for (int j = jt, it = 0; j >= 0; --j, ++it) {
        const int cur = it & 1;
        SB_GLOAD(j > 0 ? j - 1 : 0);
        const bool wdone = __all(racc > 104.f);
        if (64 * j < q0 + 16 * wave + 15 && !wdone) {
            const LAS unsigned short* Kc = Kt + cur * 64 * KTP; const LAS unsigned short* Vc = Vt + cur * 128 * VTP;
            pg8::f32x4 z[4];
#pragma unroll
            for (int s = 0; s < 4; ++s) { z[s] = (pg8::f32x4){0.f, 0.f, 0.f, 0.f};
#pragma unroll
                for (int ks = 0; ks < 4; ++ks) z[s] = __builtin_amdgcn_mfma_f32_16x16x32_bf16(*(const LAS bf16x8_t*)(Kc + (16 * s + c) * KTP + 32 * ks + 8 * g), qf[ks], z[s], 0, 0, 0); }
            float sp[4][4], t[4], xs[4]; bool mk[4][4];
#pragma unroll
            for (int s = 0; s < 4; ++s) { t[s] = 0.f;
#pragma unroll
                for (int r = 0; r < 4; ++r) { const int key = 64 * j + 16 * s + 4 * g + r; mk[s][r] = key < qrow; const float zz = z[s][r] * 0.08838834764831845f; z[s][r] = zz;
                    sp[s][r] = mk[s][r] ? softplusf_(zz) : 0.f; t[s] += sp[s][r]; } }
            float grand = 0.f, higher[4];
#pragma unroll
            for (int s = 3; s >= 0; --s) { float x = t[s]; float y = __shfl(x, lane + 16); x += (g < 3) ? y : 0.f; y = __shfl(x, lane + 32); x += (g < 2) ? y : 0.f;
                xs[s] = x - t[s];
                const float tot = __shfl(x, c); higher[s] = grand; grand += tot; }
            bf16x8_t pf[2];
#pragma unroll
            for (int s = 0; s < 4; ++s) { float a[4]; float e = 0.f;
#pragma unroll
                for (int r = 3; r >= 0; --r) { const float la = z[s][r] - sp[s][r] - (racc + higher[s] + xs[s] + e); a[r] = mk[s][r] ? __expf(la) : 0.f; e += sp[s][r]; }
                const unsigned w0 = pk2(a[0], a[1]), w1 = pk2(a[2], a[3]);
                if ((s & 1) == 0) { pf[s >> 1][0] = (short)(w0 & 0xffff); pf[s >> 1][1] = (short)(w0 >> 16); pf[s >> 1][2] = (short)(w1 & 0xffff); pf[s >> 1][3] = (short)(w1 >> 16); }
                else              { pf[s >> 1][4] = (short)(w0 & 0xffff); pf[s >> 1][5] = (short)(w0 >> 16); pf[s >> 1][6] = (short)(w1 & 0xffff); pf[s >> 1][7] = (short)(w1 >> 16); } }
            racc += grand;
#pragma unroll
            for (int dt = 0; dt < 8; ++dt)
#pragma unroll
                for (int k2 = 0; k2 < 2; ++k2) { const v2u lo = *(const LAS v2u*)(Vc + (16 * dt + c) * VTP + 32 * k2 + 4 * g), hi = *(const LAS v2u*)(Vc + (16 * dt + c) * VTP + 32 * k2 + 16 + 4 * g);
                    const v4u vv = (v4u){lo.x, lo.y, hi.x, hi.y};
                    acc[dt] = __builtin_amdgcn_mfma_f32_16x16x32_bf16(__builtin_bit_cast(bf16x8_t, vv), pf[k2], acc[dt], 0, 0, 0); }
        }
        const bool wd2 = __all(racc > 104.f);
        if (lane == 0) flags[cur * 8 + wave] = wd2 ? 1 : 0;
        SB_LWRITE(cur ^ 1);
        LDS_BAR();
        int alld = 1;
#pragma unroll
        for (int w = 0; w < 8; ++w) alld &= flags[cur * 8 + w];
        if (alld) break;
    }
#undef SB_GLOAD
#undef SB_LWRITE
#pragma unroll
    for (int dt = 0; dt < 8; ++dt) { v2u w; w.x = pk2(acc[dt][0], acc[dt][1]); w.y = pk2(acc[dt][2], acc[dt][3]); *(v2u*)(BR0 + (size_t)qrow * BW + h * 128 + 16 * dt + 4 * g) = w; }
}

__device__ __forceinline__ void phase_mixers(const Params& p, int l, LAS unsigned char* lds, int wg, int G, int tid, int wave, int lane, const XcdBarrier& bar) {
#if defined(PROBE_SPLIT)
    if (wg < 16) gdn_seq2(p, lds, wg, tid, wave, lane); else if (wg < 36) ml_seq2(p, lds, wg - 16, tid, wave, lane);
    xcd_barrier(bar);
    const int w2 = wg, G2 = G;
#else
    if (wg < 16) { gdn_seq2(p, lds, wg, tid, wave, lane); return; }
    if (wg < 36) { ml_seq2(p, lds, wg - 16, tid, wave, lane); return; }
    const int w2 = wg - 36, G2 = G - 36;
#endif
    for (int it = w2; it < 256; it += G2) mixer_gmlp_item(p, l, lds, it, tid, wave, lane);
    for (int it = w2; it < 256; it += G2) sb_unit(p, lds, it, tid, wave, lane);
}

__device__ __forceinline__ void phase_post(const Params& p, int l, int gw, int NGW, int lane) {
    const bf16* Z = (const bf16*)(p.ws + WS_Z); const float* GO = (const float*)(p.ws + WS_GO); const float* HO = (const float*)(p.ws + WS_HO); const float* HDEN = (const float*)(p.ws + WS_HDEN);
    bf16* BR2 = (bf16*)(p.ws + WS_BR) + (size_t)2 * T * BW; bf16* BR3 = (bf16*)(p.ws + WS_BR) + (size_t)3 * T * BW;
    const float* gng = p.in[I_GDNNG] + l * 128; const float* mng = p.in[I_MLNG] + l * BW;
    for (int t = gw; t < T; t += NGW) {
        {   const v4f a0 = *(const v4f*)(GO + (size_t)t * BW + 8 * lane), a1 = *(const v4f*)(GO + (size_t)t * BW + 8 * lane + 4); float o[8] = {a0.x, a0.y, a0.z, a0.w, a1.x, a1.y, a1.z, a1.w}; float ss = 0.f;
#pragma unroll
            for (int i = 0; i < 8; ++i) ss += o[i] * o[i];
            const float r = rsqrtf(sum16(ss) * (1.f / 128.f) + LN_EPS);
            const v4u graw = *(const v4u*)(Z + (size_t)t * ZC + ZC_GDNG + 8 * lane); float gt[8]; unpack8(graw, gt);
#pragma unroll
            for (int i = 0; i < 8; ++i) o[i] = o[i] * r * gng[(8 * lane + i) & 127] * siluf_(gt[i]);
            v4u w; w.x = pk2(o[0], o[1]); w.y = pk2(o[2], o[3]); w.z = pk2(o[4], o[5]); w.w = pk2(o[6], o[7]); *(v4u*)(BR2 + (size_t)t * BW + 8 * lane) = w; }
        {   const v4f a0 = *(const v4f*)(HO + (size_t)t * BW + 8 * lane), a1 = *(const v4f*)(HO + (size_t)t * BW + 8 * lane + 4); float o[8] = {a0.x, a0.y, a0.z, a0.w, a1.x, a1.y, a1.z, a1.w}; float ss = 0.f;
            const float dn = 1.f / fmaxf(fabsf(HDEN[(size_t)t * 4 + (lane >> 4)]), 1.f);
#pragma unroll
            for (int i = 0; i < 8; ++i) { o[i] *= dn; ss += o[i] * o[i]; }
            const float r = rsqrtf(sum16(ss) * (1.f / 128.f) + LN_EPS);
            const v4u graw = *(const v4u*)(Z + (size_t)t * ZC + ZC_MLO + 8 * lane); float gt[8]; unpack8(graw, gt);
#pragma unroll
            for (int i = 0; i < 8; ++i) o[i] = o[i] * r * mng[8 * lane + i] * sigmoidf_(gt[i]);
            v4u w; w.x = pk2(o[0], o[1]); w.y = pk2(o[2], o[3]); w.z = pk2(o[4], o[5]); w.w = pk2(o[6], o[7]); *(v4u*)(BR3 + (size_t)t * BW + 8 * lane) = w; }
    }
}

__device__ __forceinline__ void ln_row(const float* yrow, const float* g, const float* b, int lane, v4f (&v)[8]) {
    const v4f* yr = (const v4f*)yrow + lane; float s = 0.f;
#pragma unroll
    for (int j = 0; j < 8; ++j) { v[j] = yr[64 * j]; s += (v[j].x + v[j].y) + (v[j].z + v[j].w); }
    const float mean = wave_sum(s) * (1.f / D); float s2 = 0.f;
#pragma unroll
    for (int j = 0; j < 8; ++j) { v[j] = v[j] - mean; s2 += (v[j].x * v[j].x + v[j].y * v[j].y) + (v[j].z * v[j].z + v[j].w * v[j].w); }
    const float rstd = rsqrtf(wave_sum(s2) * (1.f / D) + LN_EPS);
#pragma unroll
    for (int j = 0; j < 8; ++j) { const v4f gg = ((const v4f*)g)[lane + 64 * j], bb = ((const v4f*)b)[lane + 64 * j]; v[j] = v[j] * rstd * gg + bb; }
}
__device__ __forceinline__ void phase_ln1_router(const Params& p, int l, LAS unsigned char* lds, int wg, int G, int wave, int lane) {
    const float* Y = (const float*)(p.ws + WS_Y); float* X1 = (float*)(p.ws + WS_X1); bf16* X1B = (bf16*)(p.ws + WS_X1B); int* LIST = (int*)(p.ws + WS_LIST); float* WL = (float*)(p.ws + WS_WL); unsigned* SLOT = (unsigned*)(p.ws + WS_SLOT);
    unsigned* cnt = (unsigned*)(p.ws + WS_CTL) + CW_CNT + l * 4096;
    const float* g1 = p.in[I_LN1G] + (size_t)l * D; const float* b1 = p.in[I_LN1B] + (size_t)l * D;
    const float* wr = p.in[I_WR] + (size_t)l * D * NE; const float rbias = p.in[I_RB][l * NE + lane];
    LAS float* xt = (LAS float*)lds;
    LAS float* part = (LAS float*)(lds + 65536);
    for (int tl = wg; tl < T / 8; tl += G) {
        const size_t m = (size_t)tl * 8 + wave;
        {   v4f v[8]; ln_row(Y + m * D, g1, b1, lane, v);
            v4f* xo = (v4f*)(X1 + m * D) + lane; v2u* xb = (v2u*)(X1B + m * D) + lane;
#pragma unroll
            for (int j = 0; j < 8; ++j) { xo[64 * j] = v[j]; v2u o; o.x = pk2(v[j].x, v[j].y); o.y = pk2(v[j].z, v[j].w); xb[64 * j] = o; *(LAS v4f*)(xt + wave * D + 4 * lane + 256 * j) = v[j]; } }
        __syncthreads();
        {   float acc[8];
#pragma unroll
            for (int r = 0; r < 8; ++r) acc[r] = 0.f;
#pragma unroll 2
            for (int d4 = 0; d4 < 64; ++d4) { const int d = wave * 256 + 4 * d4;
                const float w0 = wr[(size_t)(d + 0) * NE + lane], w1 = wr[(size_t)(d + 1) * NE + lane], w2 = wr[(size_t)(d + 2) * NE + lane], w3 = wr[(size_t)(d + 3) * NE + lane];
#pragma unroll
                for (int r = 0; r < 8; ++r) { const v4f xv = *(const LAS v4f*)(xt + r * D + d); acc[r] += xv.x * w0 + xv.y * w1 + xv.z * w2 + xv.w * w3; } }
#pragma unroll
            for (int r = 0; r < 8; ++r) part[(wave * 8 + r) * 64 + lane] = acc[r]; }
        __syncthreads();
        {   float logit = 0.f;
#pragma unroll
            for (int w = 0; w < 8; ++w) logit += part[(w * 8 + wave) * 64 + lane];
            const float s = sigmoidf_(logit), biased = s + rbias;
            const float m1 = max8(biased); const float li = (float)(lane & 7);
            const float first = min8(biased == m1 ? li : 8.f);
            const float m2 = max8(li == first ? -INFINITY : biased);
            const float gs = m1 + m2; const int myg = lane >> 3; int grank = 0;
#pragma unroll
            for (int g2 = 0; g2 < 8; ++g2) { const float o = __builtin_bit_cast(float, __builtin_amdgcn_readlane(__builtin_bit_cast(int, gs), g2 * 8)); grank += (o > gs || (o == gs && g2 < myg)) ? 1 : 0; }
            const float masked = grank < 4 ? biased : -INFINITY; int rank = 0;
#pragma unroll
            for (int e2 = 0; e2 < 64; ++e2) { const float o = __builtin_bit_cast(float, __builtin_amdgcn_readlane(__builtin_bit_cast(int, masked), e2)); rank += (o > masked || (o == masked && e2 < lane)) ? 1 : 0; }
            const float wsel = rank < 6 ? s : 0.f; const float tot = wave_sum(wsel);
            if (rank < 6) { const unsigned pos = __hip_atomic_fetch_add(cnt + 64 * lane, 1u, __ATOMIC_RELAXED, __HIP_MEMORY_SCOPE_AGENT);
                LIST[lane * T + pos] = (int)m; WL[lane * T + pos] = wsel / tot * 2.5f; SLOT[m * 8 + rank] = ((unsigned)lane << 16) | pos; } }
        __syncthreads();
    }
}
__device__ __forceinline__ void phase_combine_ln2(const Params& p, int l, float* dst, int gw, int NGW, int lane) {
    const float* X1 = (const float*)(p.ws + WS_X1); const bf16* YE = (const bf16*)(p.ws + WS_YEXP); const unsigned* SLOT = (const unsigned*)(p.ws + WS_SLOT);
    const unsigned* cnt = (const unsigned*)(p.ws + WS_CTL) + CW_CNT + l * 4096;
    const float* g2 = p.in[I_LN2G] + (size_t)l * D; const float* b2 = p.in[I_LN2B] + (size_t)l * D;
    const int tiles = ((int)cnt[64 * lane] + 255) >> 8; const float incl = wave_scan_incl((float)tiles);
    const int toff = (int)incl - tiles;
    const int tsh = __builtin_amdgcn_readlane((int)incl, 63);
    for (int m = gw; m < T; m += NGW) {
        v4f v[8]; const v4f* xr = (const v4f*)(X1 + (size_t)m * D) + lane;
#pragma unroll
        for (int j = 0; j < 8; ++j) v[j] = xr[64 * j] * ALPHA;
#pragma unroll
        for (int k = 0; k < 7; ++k) { size_t row;
            if (k == 0) row = (size_t)tsh * 256 + m;
            else { const unsigned s = __builtin_amdgcn_readfirstlane(SLOT[(size_t)m * 8 + (k - 1)]); const int e = (int)(s >> 16); row = (size_t)__builtin_amdgcn_readlane(toff, e) * 256 + (s & 0xffffu); }
            const v2u* yr = (const v2u*)(YE + row * D) + lane;
#pragma unroll
            for (int j = 0; j < 8; ++j) { const v2u y = yr[64 * j]; v[j].x += bflo(y.x); v[j].y += bfhi(y.x); v[j].z += bflo(y.y); v[j].w += bfhi(y.y); } }
        float s = 0.f;
#pragma unroll
        for (int j = 0; j < 8; ++j) s += (v[j].x + v[j].y) + (v[j].z + v[j].w);
        const float mean = wave_sum(s) * (1.f / D); float s2 = 0.f;
#pragma unroll
        for (int j = 0; j < 8; ++j) { v[j] = v[j] - mean; s2 += (v[j].x * v[j].x + v[j].y * v[j].y) + (v[j].z * v[j].z + v[j].w * v[j].w); }
        const float rstd = rsqrtf(wave_sum(s2) * (1.f / D) + LN_EPS);
        v4f* xo = (v4f*)(dst + (size_t)m * D) + lane;
#pragma unroll
        for (int j = 0; j < 8; ++j) { const v4f gg = ((const v4f*)g2)[lane + 64 * j], bb = ((const v4f*)b2)[lane + 64 * j]; xo[64 * j] = v[j] * rstd * gg + bb; }
    }
}

constexpr int NPH = 11;
template <class S> struct DupOrder {
    S s; int n;
    __device__ __forceinline__ bool next(int i, Unit& u) const { return s.next(i >= n ? i - n : i, u); }
    __device__ __forceinline__ int row_token(int i, int r) const { return s.row_token(i >= n ? i - n : i, r); }
    __device__ __forceinline__ void a_ready(const Unit& u) const { s.a_ready(u); }
    __device__ __forceinline__ void done(const Unit& u) const { s.done(u); }
};
template <class S> __device__ __forceinline__ int count_units(const S& s) { Unit u; int n = 0; while (n < 64 && s.next(n, u)) ++n; return n; }
#define ORDER_T(k, T) typename std::conditional<PROBE_DUP == (k), DupOrder<T>, T>::type
template <class S> __device__ __forceinline__ DupOrder<S> make_order(const S& s, std::true_type) { DupOrder<S> d{s, count_units(s)}; d.n = count_units(s); return d; }
template <class S> __device__ __forceinline__ S make_order(const S& s, std::false_type) { return s; }
#define MAKE_ORDER(k, s) make_order(s, std::integral_constant<bool, PROBE_DUP == (k)>())
template <int l>
__device__ __forceinline__ void run_layer(const Params& p, LAS unsigned char* lds, const XcdBarrier& bar, int tid, int lane, int wave, int G, int wg, int gw, int NGW) {
    unsigned char* ws = p.ws;
    {
        const float* xin = (l == 0) ? p.in[I_X] : (const float*)(ws + WS_XCUR);
        float* xout = (l == NL - 1) ? p.out : (float*)(ws + WS_XCUR);
#ifndef PROBE_DUP
#define PROBE_DUP (-1)
#endif
#define IS_GEMM_PH(k) ((k) == 1 || (k) == 5 || (k) == 6 || (k) == 8 || (k) == 9)
#define REP(k) for (int _r = 0; _r < ((PROBE_DUP == (k) && !IS_GEMM_PH(k)) ? 2 : 1); ++_r)
#ifndef PH_MASK
#define PH_MASK 0x7ff
#endif
#define RUN(k) (((PH_MASK >> (k)) & 1) && p.ph_lo <= l * NPH + (k) && l * NPH + (k) < p.ph_hi)
#define SEAM(k) do { if (l * NPH + (k) + 1 < p.ph_hi) xcd_barrier(bar); } while (0)
        if (RUN(0)) { REP(0) { phase_convert(p, l, lds, gw, NGW, wave, lane); phase_xprep(p, l, xin, lds, gw, NGW, tid, lane); } SEAM(0); }
        if (RUN(1)) { REP(1) { pg8::Gemm g{(const bf16*)(ws + WS_XB), (const bf16*)(ws + WS_WIN), T, ZC, D, D, D}; pg8::StaticOrder S; S.init(T, ZC, G, wg);
            pg8::EpiBf16<0> E{(bf16*)(ws + WS_Z), ZC, nullptr, 0, 0, 1.f};
            auto S2 = MAKE_ORDER(1, S); pg8::gemm_phase<pg8::EpiBf16<0>, ORDER_T(1, pg8::StaticOrder), true, true>(lds, g, S2, E); } SEAM(1); }
        if (RUN(2)) { REP(2) { for (int it = wg; it < 1536; it += G) { if (it < 512) gdn_pre_item(p, l, lds, it, tid, wave, lane); else if (it < 1024) ml_pre_item(p, l, lds, it - 512, tid, wave, lane); else vt_item(p, lds, it - 1024, tid); } } SEAM(2); }
        if (RUN(3)) { REP(3) { phase_mixers(p, l, lds, wg, G, tid, wave, lane, bar); } SEAM(3); }
        if (RUN(4)) { REP(4) { phase_post(p, l, gw, NGW, lane); } SEAM(4); }
        if (RUN(5)) { REP(5) { pg8::Gemm g{(const bf16*)(ws + WS_BR), (const bf16*)(ws + WS_WBR), 4 * T, 4 * D, BW, BW, BW}; MergeOrder S{G, wg};
            EpiMerge E{(const bf16*)(ws + WS_Z), (float*)(ws + WS_MTMP), (bf16*)(ws + WS_MSUM)};
            auto S2 = MAKE_ORDER(5, S); pg8::gemm_phase<EpiMerge, ORDER_T(5, MergeOrder), true, true>(lds, g, S2, E); } SEAM(5); }
        if (RUN(6)) { REP(6) { pg8::Gemm g{(const bf16*)(ws + WS_MSUM), (const bf16*)(ws + WS_WOUT), T, D, D, D, D}; pg8::StaticOrder S; S.init(T, D, G, wg);
            EpiResid E{xin, (float*)(ws + WS_Y)};
            auto S2 = MAKE_ORDER(6, S); pg8::gemm_phase<EpiResid, ORDER_T(6, pg8::StaticOrder), true, true>(lds, g, S2, E); } SEAM(6); }
        if (RUN(7)) { REP(7) { phase_ln1_router(p, l, lds, wg, G, wave, lane); } SEAM(7); }
        if (RUN(8)) { REP(8) { const unsigned* cnt = (const unsigned*)(ws + WS_CTL) + CW_CNT + l * 4096; MoeTab M(lds); moe_tables(M, cnt, tid, lane, wave);
            UpOrder S{M, 0}; S.n = up_order_build(M, (const int*)(ws + WS_LIST), (const float*)(ws + WS_WL), wg, G, tid);
            pg8::Gemm g{(const bf16*)(ws + WS_X1B), (const bf16*)(ws + WS_WUP), T, NEX * 1024, D, D, D};
            EpiGluSparse E{(LAS const float*)M.wt, (bf16*)(ws + WS_HB)};
            auto S2 = MAKE_ORDER(8, S); pg8::gemm_phase_gather<EpiGluSparse, ORDER_T(8, UpOrder)>(lds, g, S2, E); } SEAM(8); }
        if (RUN(9)) { REP(9) { const unsigned* cnt = (const unsigned*)(ws + WS_CTL) + CW_CNT + l * 4096; MoeTab M(lds); moe_tables(M, cnt, tid, lane, wave);
            DownOrder S{M, G, wg, 8 * M.t[65]};
            pg8::Gemm g{(const bf16*)(ws + WS_HB), (const bf16*)(ws + WS_WDN), HROWS, NEX * D, ED, ED, ED};
            EpiYexp E{(bf16*)(ws + WS_YEXP)};
            auto S2 = MAKE_ORDER(9, S); pg8::gemm_phase<EpiYexp, ORDER_T(9, DownOrder), true, true>(lds, g, S2, E); } SEAM(9); }
        if (RUN(10)) { REP(10) { phase_combine_ln2(p, l, xout, gw, NGW, lane); } SEAM(10); }
#undef RUN
#undef SEAM
    }
}
__global__ void __launch_bounds__(512, 2) fwd_kernel(Params p) {
    extern __shared__ __attribute__((aligned(16))) unsigned char lds_raw[];
    LAS unsigned char* lds = (LAS unsigned char*)lds_raw;
    const int tid = threadIdx.x, lane = tid & 63, wave = __builtin_amdgcn_readfirstlane(tid >> 6);
    const int G = gridDim.x, wg = blockIdx.x, gw = wg * 8 + wave, NGW = G * 8;
    volatile LAS unsigned* MISC = (volatile LAS unsigned*)(lds + MISC_OFF);
    if (tid < 32) MISC[tid] = 0u;
    __syncthreads();
    unsigned* ctl = (unsigned*)(p.ws + WS_CTL);
    const bool multi = (p.ph_hi - p.ph_lo) > 1;
    XcdBarrier bar; bar.bar = ctl + CW_BAR; bar.x = 0; bar.st = nullptr;
    if (multi) bar = xcd_barrier_post(ctl + CW_BAR, MISC + 8);
    run_layer<0>(p, lds, bar, tid, lane, wave, G, wg, gw, NGW);
    run_layer<1>(p, lds, bar, tid, lane, wave, G, wg, gw, NGW);
}

#ifndef MK_MULTI_LAUNCH
#define MK_MULTI_LAUNCH 0
#endif
extern "C" void kernel_launch(void* const* d_in, const int* in_sizes, int n_in, void* d_out, int out_size, void* d_ws, size_t ws_size, hipStream_t stream) {
    static int grid = 0;
    if (grid == 0) {
        if (n_in != 27 || out_size != T * D || ws_size < WS_END) { fprintf(stderr, "kernel_launch: unexpected shapes (n_in %d out %d ws %zu need %zu)\n", n_in, out_size, ws_size, (size_t)WS_END); grid = -1; return; }
        int dev = 0, cus = 0, per_cu = 0;
        if (hipGetDevice(&dev) != hipSuccess || hipDeviceGetAttribute(&cus, hipDeviceAttributeMultiprocessorCount, dev) != hipSuccess) { grid = -1; return; }
        if (hipFuncSetAttribute((const void*)fwd_kernel, hipFuncAttributeMaxDynamicSharedMemorySize, LDS_BYTES) != hipSuccess) { fprintf(stderr, "kernel_launch: hipFuncSetAttribute failed\n"); grid = -1; return; }
        if (hipOccupancyMaxActiveBlocksPerMultiprocessor(&per_cu, (const void*)fwd_kernel, 512, LDS_BYTES) != hipSuccess || per_cu < 1) { fprintf(stderr, "kernel_launch: occupancy query says %d\n", per_cu); }
        (void)hipGetLastError();
        grid = cus;
    }
    if (grid < 0) return;
    (void)hipMemsetAsync((char*)d_ws + WS_CTL, 0, CTL_ZERO_BYTES, stream);
    Params p{};
    for (int i = 0; i < 27; ++i) p.in[i] = (const float*)d_in[i];
    p.out = (float*)d_out; p.ws = (unsigned char*)d_ws;
#if MK_MULTI_LAUNCH
    for (int ph = 0; ph < NL * NPH; ++ph) { p.ph_lo = ph; p.ph_hi = ph + 1; hipLaunchKernelGGL(fwd_kernel, dim3(grid), dim3(512), LDS_BYTES, stream, p); }
#else
    p.ph_lo = 0; p.ph_hi = NL * NPH; hipLaunchKernelGGL(fwd_kernel, dim3(grid), dim3(512), LDS_BYTES, stream, p);
#endif
}
```

```cpp
#include <hip/hip_runtime.h>
#include <cstdio>
#include <cstdint>
#include <type_traits>
namespace pg8 {
#define PG8_LAS __attribute__((address_space(3)))
typedef unsigned short bf16_t;
typedef short bf16x8 __attribute__((ext_vector_type(8)));
typedef float f32x4 __attribute__((ext_vector_type(4)));
typedef unsigned u32x4 __attribute__((ext_vector_type(4)));
constexpr int BM = 256, BK = 64, HALF = 128, HTB = HALF * BK * 2  , STAGE_BYTES = 8 * HTB, NXCD = 8, WGM = 8;

__host__ __device__ __forceinline__ int lds_byte(int r, int c) { const int st = (r >> 4) * 2 + (c >> 5), rr = r & 15, cc = c & 31, ob = rr * 64 + cc * 2; return st * 1024 + (ob ^ (((ob >> 9) & 1) << 5)); }
__host__ __device__ __forceinline__ void stage_rc(int b, int& R, int& C) { const int st = b / 1024, sb = b % 1024, swz = sb ^ (((sb >> 9) & 1) << 5); R = (st >> 1) * 16 + swz / 64; C = (st & 1) * 32 + (swz % 64) / 2; }
__host__ __device__ __forceinline__ int perm32(int rho) { const int n = rho >> 4, i = rho & 15; return 8 * (i >> 2) + 4 * n + (i & 3); }

struct Unit { int pm, pn, aux; };
struct Gemm { const bf16_t* A; const bf16_t* Bt; int M, N, K, lda, ldb; };

struct StaticOrder {
    int nM, nN, nwg, G, c;
    __host__ __device__ void init(int M, int N, int G_, int c_) { nM = M / BM; nN = N / BM; nwg = nM * nN; G = G_; c = c_; }
    __host__ __device__ bool next(int i, Unit& u) const {
        const long L = (long)i * G + c; if (L >= nwg) return false;
        int wgid = (int)L; { const int q = nwg / NXCD, r = nwg % NXCD, xcd = wgid % NXCD, off = wgid / NXCD; wgid = (xcd < r ? xcd * (q + 1) : r * (q + 1) + (xcd - r) * q) + off; }
        const int nig = WGM * nN, gid = wgid / nig, fm = gid * WGM, gsz = (nM - fm) < WGM ? (nM - fm) : WGM;
        u.pm = fm + ((wgid % nig) % gsz); u.pn = (wgid % nig) / gsz; return true;
    }
    __device__ __forceinline__ void a_ready(const Unit&) const {}
    __device__ __forceinline__ void done(const Unit&) const {}
};

__device__ __forceinline__ unsigned cvt_pk_bf16(float lo, float hi) { unsigned r; asm volatile("v_cvt_pk_bf16_f32 %0, %1, %2" : "=v"(r) : "v"(lo), "v"(hi)); return r; }
typedef float f32x2 __attribute__((ext_vector_type(2)));
__device__ __forceinline__ f32x2 gelu_pk(f32x2 v) {
    const f32x2 av = __builtin_elementwise_abs(v), d = av * 0.2316418882f + 1.0f;
    f32x2 t; t.x = __builtin_amdgcn_rcpf(d.x); t.y = __builtin_amdgcn_rcpf(d.y);
    f32x2 q = t * 0.5307027145f + (-0.7265760135f); q = q * t + 0.7107068705f; q = q * t + (-0.142248368f); q = q * t + 0.127414796f; q = q * t;
    const f32x2 s = (v * v) * (-0.72134752044f);
    f32x2 e; e.x = __builtin_amdgcn_exp2f(s.x); e.y = __builtin_amdgcn_exp2f(s.y);
    const f32x2 m = v * (q * e), r = v - m;
    f32x2 o; o.x = v.x < 0.f ? m.x : r.x; o.y = v.y < 0.f ? m.y : r.y; return o;
}

template <int ACT  > struct EpiBf16 {
    static constexpr bool PERM = true, AFTER_DRAIN = false; static_assert(ACT == 0 || ACT == 1, "EpiBf16: ACT is 0 (none) or 1 (gelu_pk)");
    bf16_t* O; int ldc; const float* bias; int split_cols; size_t split_stride; float scale0;
    __device__ __forceinline__ void operator()(const f32x4 (&acc)[2][2][4][2], const Unit& u, int wr, int wc, int fr, int fq) const {
        const int row0 = u.pm * BM + wr * 64 + fr; int colt = u.pn * BM; bf16_t* base = O;
        float sc = 1.f; if (split_cols) { const int t = colt / split_cols; base += (size_t)t * split_stride; colt -= t * split_cols; if (t == 0) sc = scale0; }
        const int col0 = colt + wc * 32 + 8 * fq, bcol0 = u.pn * BM + wc * 32 + 8 * fq;
        f32x4 bv[2][2];
#pragma unroll
        for (int bj = 0; bj < 2; ++bj)
#pragma unroll
            for (int n = 0; n < 2; ++n) bv[bj][n] = bias ? *(const f32x4*)(bias + bcol0 + bj * HALF + 4 * n) : (f32x4){0.f, 0.f, 0.f, 0.f};
#pragma unroll
        for (int ai = 0; ai < 2; ++ai)
#pragma unroll
            for (int m = 0; m < 4; ++m) { bf16_t* rowp = base + (size_t)(row0 + ai * HALF + m * 16) * ldc + col0;
#pragma unroll
                for (int bj = 0; bj < 2; ++bj) { f32x4 v0 = acc[ai][bj][m][0] + bv[bj][0], v1 = acc[ai][bj][m][1] + bv[bj][1];
                    if (ACT == 1) { f32x2 a = gelu_pk((f32x2){v0[0], v0[1]}), b = gelu_pk((f32x2){v0[2], v0[3]}), c = gelu_pk((f32x2){v1[0], v1[1]}), d = gelu_pk((f32x2){v1[2], v1[3]});
                        v0 = (f32x4){a.x, a.y, b.x, b.y}; v1 = (f32x4){c.x, c.y, d.x, d.y}; }
                    v0 = v0 * sc; v1 = v1 * sc; u32x4 w; w.x = cvt_pk_bf16(v0[0], v0[1]); w.y = cvt_pk_bf16(v0[2], v0[3]); w.z = cvt_pk_bf16(v1[0], v1[1]); w.w = cvt_pk_bf16(v1[2], v1[3]);
                    *(u32x4*)(rowp + bj * HALF) = w; } }
    }
};

template <class Epi, class Sched, bool ALIGN_EPI = false, bool SP2 = false>
__device__ __forceinline__ void gemm_phase(PG8_LAS unsigned char* lds, const Gemm g, const Sched& S, const Epi& E) {
    const int tid = threadIdx.x, wid = __builtin_amdgcn_readfirstlane(tid >> 6), lane = tid & 63, wr = wid >> 2, wc = wid & 3, fr = lane & 15, fq = lane >> 4;
    const int K = g.K, nt = K / BK;
    unsigned voffA[2], voffB[2];
#pragma unroll
    for (int i = 0; i < 2; ++i) { int R, C; stage_rc(tid * 16 + i * 8192, R, C); const int Rb = Epi::PERM ? ((R & ~31) + perm32(R & 31)) : R;
        voffA[i] = (unsigned)(R * g.lda + C) * 2u; voffB[i] = (unsigned)(Rb * g.ldb + C) * 2u; }
    const size_t kstep = (size_t)(BK * 2);
    const size_t hstepA = (size_t)HALF * g.lda * 2, hstepB = (size_t)HALF * g.ldb * 2;
    const size_t tstepA = 2 * hstepA, tstepB = 2 * hstepB;
    const unsigned ldsw = (unsigned)wid * 1024u;
    const int aoff = lds_byte(wr * 64 + fr, fq * 8), boff = lds_byte(wc * 32 + fr, fq * 8);
#define PG8_SA(b, h) (((b) * 2 + (h)) * HTB)
#define PG8_SB(b, h) ((4 + (b) * 2 + (h)) * HTB)
#define PG8_STAGE(bufoff, gbase, voff) do { _Pragma("unroll") for (int _i = 0; _i < 2; ++_i) \
        __builtin_amdgcn_global_load_lds((const unsigned*)((const char*)(gbase) + (voff)[_i]), (PG8_LAS unsigned*)(lds + (bufoff) + ldsw + _i * 8192), 16, 0, 0); } while (0)
#define PG8_LDA(dst, b, h) do { _Pragma("unroll") for (int m = 0; m < 4; ++m) _Pragma("unroll") for (int k = 0; k < 2; ++k) dst[m][k] = *(const PG8_LAS bf16x8*)(lds + PG8_SA(b, h) + aoff + m * 2048 + k * 1024); } while (0)
#define PG8_LDB(dst, b, h) do { _Pragma("unroll") for (int n = 0; n < 2; ++n) _Pragma("unroll") for (int k = 0; k < 2; ++k) dst[n][k] = *(const PG8_LAS bf16x8*)(lds + PG8_SB(b, h) + boff + n * 2048 + k * 1024); } while (0)
#define PG8_MMA(ai, bj, At, Bt) do { __builtin_amdgcn_s_setprio(1); _Pragma("unroll") for (int m = 0; m < 4; ++m) _Pragma("unroll") for (int n = 0; n < 2; ++n) _Pragma("unroll") for (int k = 0; k < 2; ++k) \
        acc[ai][bj][m][n] = __builtin_amdgcn_mfma_f32_16x16x32_bf16(Bt[n][k], At[m][k], acc[ai][bj][m][n], 0, 0, 0); __builtin_amdgcn_s_setprio(0); } while (0)
#define PG8_WAIT_V(n) asm volatile("s_waitcnt vmcnt(" #n ")" ::: "memory")
#define PG8_WAIT_L(n) asm volatile("s_waitcnt lgkmcnt(" #n ")" ::: "memory")
#define PG8_BAR __builtin_amdgcn_s_barrier()
#define PG8_SCHED __builtin_amdgcn_sched_barrier(0)
    Unit cur, nxt; int ui = 0;
    if (!S.next(0, cur)) return;
    f32x4 acc[2][2][4][2];
#pragma unroll
    for (int a = 0; a < 2; ++a)
#pragma unroll
        for (int b = 0; b < 2; ++b)
#pragma unroll
            for (int m = 0; m < 4; ++m)
#pragma unroll
                for (int n = 0; n < 2; ++n) acc[a][b][m][n] = (f32x4){0.f, 0.f, 0.f, 0.f};
    bf16x8 At[4][2], B0[2][2], B1[2][2];
    const char* cA = (const char*)g.A + (size_t)cur.pm * tstepA; const char* cB = (const char*)g.Bt + (size_t)cur.pn * tstepB;
    S.a_ready(cur);
    if constexpr (SP2) {
        PG8_STAGE(PG8_SB(0, 0), cB, voffB); PG8_STAGE(PG8_SB(0, 1), cB + hstepB, voffB); PG8_STAGE(PG8_SA(0, 0), cA, voffA); PG8_STAGE(PG8_SA(0, 1), cA + hstepA, voffA);
        if (wr == 1) PG8_BAR;
        PG8_WAIT_V(2); PG8_BAR;
        PG8_STAGE(PG8_SB(1, 0), cB + kstep, voffB); PG8_STAGE(PG8_SA(1, 0), cA + kstep, voffA); PG8_STAGE(PG8_SB(1, 1), cB + hstepB + kstep, voffB);
        PG8_WAIT_V(6); PG8_BAR;
    } else {
        PG8_STAGE(PG8_SB(0, 0), cB, voffB); PG8_STAGE(PG8_SA(0, 0), cA, voffA); PG8_STAGE(PG8_SB(0, 1), cB + hstepB, voffB); PG8_STAGE(PG8_SA(0, 1), cA + hstepA, voffA);
        if (wr == 1) PG8_BAR;
        PG8_WAIT_V(4); PG8_BAR;
        PG8_STAGE(PG8_SB(1, 0), cB + kstep, voffB); PG8_STAGE(PG8_SA(1, 0), cA + kstep, voffA); PG8_STAGE(PG8_SB(1, 1), cB + hstepB + kstep, voffB);
        PG8_WAIT_V(6); PG8_BAR;
    }
    for (;;) {
        const bool has_next = S.next(ui + 1, nxt);
        const char* nA = has_next ? (const char*)g.A + (size_t)nxt.pm * tstepA : cA; const char* nB = has_next ? (const char*)g.Bt + (size_t)nxt.pn * tstepB : cB;
        for (int t = 0; t < nt; t += 2) {
            const bool last = (t == nt - 2);
            const char* a1 = cA + (size_t)(t + 1) * kstep;
            const char* a2 = last ? nA : cA + (size_t)(t + 2) * kstep; const char* b2 = last ? nB : cB + (size_t)(t + 2) * kstep;
            const char* a3 = a2 + kstep; const char* b3 = b2 + kstep;
            if (last && has_next) S.a_ready(nxt);
            if constexpr (SP2) {
            PG8_LDB(B0, 0, 0); PG8_LDB(B1, 0, 1); PG8_SCHED; PG8_LDA(At, 0, 0); PG8_STAGE(PG8_SA(1, 1), a1 + hstepA, voffA);
            PG8_WAIT_V(8); PG8_WAIT_L(0); PG8_BAR; PG8_MMA(0, 0, At, B0); PG8_MMA(0, 1, At, B1); PG8_BAR; PG8_SCHED;
            PG8_LDA(At, 0, 1); PG8_STAGE(PG8_SB(0, 0), b2, voffB); PG8_STAGE(PG8_SB(0, 1), b2 + hstepB, voffB); PG8_STAGE(PG8_SA(0, 0), a2, voffA);
            PG8_WAIT_V(8); PG8_WAIT_L(0); PG8_BAR; PG8_MMA(1, 0, At, B0); PG8_MMA(1, 1, At, B1); PG8_BAR; PG8_SCHED;
            PG8_LDB(B0, 1, 0); PG8_LDB(B1, 1, 1); PG8_SCHED; PG8_LDA(At, 1, 0); PG8_STAGE(PG8_SA(0, 1), a2 + hstepA, voffA);
            PG8_WAIT_V(8); PG8_WAIT_L(0); PG8_BAR; PG8_MMA(0, 0, At, B0); PG8_MMA(0, 1, At, B1); PG8_BAR; PG8_SCHED;
            PG8_LDA(At, 1, 1); PG8_STAGE(PG8_SB(1, 0), b3, voffB); PG8_STAGE(PG8_SB(1, 1), b3 + hstepB, voffB); PG8_STAGE(PG8_SA(1, 0), a3, voffA);
            PG8_WAIT_V(8); PG8_WAIT_L(0); PG8_BAR; PG8_MMA(1, 0, At, B0); PG8_MMA(1, 1, At, B1); PG8_BAR; PG8_SCHED;
            } else {
            PG8_LDB(B0, 0, 0); PG8_SCHED; PG8_LDA(At, 0, 0); PG8_STAGE(PG8_SA(1, 1), a1 + hstepA, voffA);
            PG8_WAIT_L(8); PG8_BAR; PG8_WAIT_L(0); PG8_MMA(0, 0, At, B0); PG8_BAR; PG8_SCHED;
            PG8_LDB(B1, 0, 1); PG8_STAGE(PG8_SB(0, 0), b2, voffB);
            PG8_BAR; PG8_WAIT_L(0); PG8_MMA(0, 1, At, B1); PG8_BAR;
            PG8_LDA(At, 0, 1); PG8_STAGE(PG8_SA(0, 0), a2, voffA);
            PG8_BAR; PG8_WAIT_L(0); PG8_MMA(1, 0, At, B0); PG8_BAR; PG8_SCHED;
            PG8_STAGE(PG8_SB(0, 1), b2 + hstepB, voffB);
            PG8_WAIT_V(6); PG8_BAR; PG8_MMA(1, 1, At, B1); PG8_BAR;
            PG8_LDB(B0, 1, 0); PG8_SCHED; PG8_LDA(At, 1, 0); PG8_STAGE(PG8_SA(0, 1), a2 + hstepA, voffA);
            PG8_WAIT_L(8); PG8_BAR; PG8_WAIT_L(0); PG8_MMA(0, 0, At, B0); PG8_BAR; PG8_SCHED;
            PG8_LDB(B1, 1, 1); PG8_STAGE(PG8_SB(1, 0), b3, voffB);
            PG8_BAR; PG8_WAIT_L(0); PG8_MMA(0, 1, At, B1); PG8_BAR;
            PG8_LDA(At, 1, 1); PG8_STAGE(PG8_SA(1, 0), a3, voffA);
            PG8_BAR; PG8_WAIT_L(0); PG8_MMA(1, 0, At, B0); PG8_BAR; PG8_SCHED;
            PG8_STAGE(PG8_SB(1, 1), b3 + hstepB, voffB);
            PG8_WAIT_V(6); PG8_BAR; PG8_MMA(1, 1, At, B1); PG8_BAR;
            }
        }
        if constexpr (ALIGN_EPI) { if (wr == 0) PG8_BAR; }
        if constexpr (!Epi::AFTER_DRAIN) { E(acc, cur, wr, wc, fr, fq); S.done(cur); }
        if (!has_next) break;
#pragma unroll
        for (int a = 0; a < 2; ++a)
#pragma unroll
            for (int b = 0; b < 2; ++b)
#pragma unroll
                for (int m = 0; m < 4; ++m)
#pragma unroll
                    for (int n = 0; n < 2; ++n) acc[a][b][m][n] = (f32x4){0.f, 0.f, 0.f, 0.f};
        cur = nxt; cA = nA; cB = nB; ++ui;
        if constexpr (ALIGN_EPI) { if (wr == 1) PG8_BAR; }
    }
    PG8_WAIT_V(0);
    if constexpr (!ALIGN_EPI) { if (wr == 0) PG8_BAR; }
    PG8_BAR;
    if constexpr (Epi::AFTER_DRAIN) { E.fused(acc, cur, wr, wc, fr, fq, lds, wid, lane); S.done(cur); }
#undef PG8_SA
#undef PG8_SB
#undef PG8_STAGE
#undef PG8_LDA
#undef PG8_LDB
#undef PG8_MMA
#undef PG8_WAIT_V
#undef PG8_WAIT_L
#undef PG8_BAR
#undef PG8_SCHED
}
template <class Epi, class Sched>
__device__ __forceinline__ void gemm_phase_gather(PG8_LAS unsigned char* lds, const Gemm g, const Sched& S, const Epi& E) {
    const int tid = threadIdx.x, wid = __builtin_amdgcn_readfirstlane(tid >> 6), lane = tid & 63, wr = wid >> 2, wc = wid & 3, fr = lane & 15, fq = lane >> 4;
    const int K = g.K, nt = K / BK;
    unsigned voffB[2]; int RA[2], CA[2];
#pragma unroll
    for (int i = 0; i < 2; ++i) { int R, C; stage_rc(tid * 16 + i * 8192, R, C); const int Rb = Epi::PERM ? ((R & ~31) + perm32(R & 31)) : R;
        RA[i] = R; CA[i] = C; voffB[i] = (unsigned)(Rb * g.ldb + C) * 2u; }
    const size_t kstep = (size_t)(BK * 2);
    const size_t hstepB = (size_t)HALF * g.ldb * 2, tstepB = 2 * hstepB;
    const unsigned ldsw = (unsigned)wid * 1024u;
    const int aoff = lds_byte(wr * 64 + fr, fq * 8), boff = lds_byte(wc * 32 + fr, fq * 8);
#define PG8_SA(b, h) (((b) * 2 + (h)) * HTB)
#define PG8_SB(b, h) ((4 + (b) * 2 + (h)) * HTB)
#define PG8_STAGE(bufoff, gbase, voff) do { _Pragma("unroll") for (int _i = 0; _i < 2; ++_i) \
        __builtin_amdgcn_global_load_lds((const unsigned*)((const char*)(gbase) + (voff)[_i]), (PG8_LAS unsigned*)(lds + (bufoff) + ldsw + _i * 8192), 16, 0, 0); } while (0)
#define PG8_LDA(dst, b, h) do { _Pragma("unroll") for (int m = 0; m < 4; ++m) _Pragma("unroll") for (int k = 0; k < 2; ++k) dst[m][k] = *(const PG8_LAS bf16x8*)(lds + PG8_SA(b, h) + aoff + m * 2048 + k * 1024); } while (0)
#define PG8_LDB(dst, b, h) do { _Pragma("unroll") for (int n = 0; n < 2; ++n) _Pragma("unroll") for (int k = 0; k < 2; ++k) dst[n][k] = *(const PG8_LAS bf16x8*)(lds + PG8_SB(b, h) + boff + n * 2048 + k * 1024); } while (0)
#define PG8_MMA(ai, bj, At, Bt) do { __builtin_amdgcn_s_setprio(1); _Pragma("unroll") for (int m = 0; m < 4; ++m) _Pragma("unroll") for (int n = 0; n < 2; ++n) _Pragma("unroll") for (int k = 0; k < 2; ++k) \
        acc[ai][bj][m][n] = __builtin_amdgcn_mfma_f32_16x16x32_bf16(Bt[n][k], At[m][k], acc[ai][bj][m][n], 0, 0, 0); __builtin_amdgcn_s_setprio(0); } while (0)
#define PG8_WAIT_V(n) asm volatile("s_waitcnt vmcnt(" #n ")" ::: "memory")
#define PG8_WAIT_L(n) asm volatile("s_waitcnt lgkmcnt(" #n ")" ::: "memory")
#define PG8_BAR __builtin_amdgcn_s_barrier()
#define PG8_SCHED __builtin_amdgcn_sched_barrier(0)
#define PG8_ROWS(dst, ui_) do { _Pragma("unroll") for (int _h = 0; _h < 2; ++_h) _Pragma("unroll") for (int _i = 0; _i < 2; ++_i) \
        dst[_h][_i] = (unsigned)S.row_token((ui_), _h * HALF + RA[_i]) * (unsigned)(g.lda * 2) + (unsigned)(CA[_i] * 2); } while (0)
    Unit cur, nxt; int ui = 0;
    if (!S.next(0, cur)) return;
    f32x4 acc[2][2][4][2];
#pragma unroll
    for (int a = 0; a < 2; ++a)
#pragma unroll
        for (int b = 0; b < 2; ++b)
#pragma unroll
            for (int m = 0; m < 4; ++m)
#pragma unroll
                for (int n = 0; n < 2; ++n) acc[a][b][m][n] = (f32x4){0.f, 0.f, 0.f, 0.f};
    bf16x8 At[4][2], B0[2][2], B1[2][2];
    unsigned offC[2][2];
    PG8_ROWS(offC, 0);
    const char* gA = (const char*)g.A;
    const char* cB = (const char*)g.Bt + (size_t)cur.pn * tstepB;
    PG8_STAGE(PG8_SB(0, 0), cB, voffB); PG8_STAGE(PG8_SB(0, 1), cB + hstepB, voffB); PG8_STAGE(PG8_SA(0, 0), gA, offC[0]); PG8_STAGE(PG8_SA(0, 1), gA, offC[1]);
    if (wr == 1) PG8_BAR;
    PG8_WAIT_V(2); PG8_BAR;
    PG8_STAGE(PG8_SB(1, 0), cB + kstep, voffB); PG8_STAGE(PG8_SA(1, 0), gA + kstep, offC[0]); PG8_STAGE(PG8_SB(1, 1), cB + hstepB + kstep, voffB);
    PG8_WAIT_V(6); PG8_BAR;
    for (;;) {
        const bool has_next = S.next(ui + 1, nxt);
        const char* nB = has_next ? (const char*)g.Bt + (size_t)nxt.pn * tstepB : cB;
        for (int t = 0; t < nt; t += 2) {
            const bool last = (t == nt - 2);
            const char* a1 = gA + (size_t)(t + 1) * kstep;
            const char* a2 = last ? gA : gA + (size_t)(t + 2) * kstep; const char* b2 = last ? nB : cB + (size_t)(t + 2) * kstep;
            const char* a3 = a2 + kstep; const char* b3 = b2 + kstep;
            PG8_LDB(B0, 0, 0); PG8_LDB(B1, 0, 1); PG8_SCHED; PG8_LDA(At, 0, 0); PG8_STAGE(PG8_SA(1, 1), a1, offC[1]);
            if (last && has_next) { PG8_ROWS(offC, ui + 1); }
            PG8_WAIT_V(8); PG8_WAIT_L(0); PG8_BAR; PG8_MMA(0, 0, At, B0); PG8_MMA(0, 1, At, B1); PG8_BAR; PG8_SCHED;
            PG8_LDA(At, 0, 1); PG8_STAGE(PG8_SB(0, 0), b2, voffB); PG8_STAGE(PG8_SB(0, 1), b2 + hstepB, voffB); PG8_STAGE(PG8_SA(0, 0), a2, offC[0]);
            PG8_WAIT_V(8); PG8_WAIT_L(0); PG8_BAR; PG8_MMA(1, 0, At, B0); PG8_MMA(1, 1, At, B1); PG8_BAR; PG8_SCHED;
            PG8_LDB(B0, 1, 0); PG8_LDB(B1, 1, 1); PG8_SCHED; PG8_LDA(At, 1, 0); PG8_STAGE(PG8_SA(0, 1), a2, offC[1]);
            PG8_WAIT_V(8); PG8_WAIT_L(0); PG8_BAR; PG8_MMA(0, 0, At, B0); PG8_MMA(0, 1, At, B1); PG8_BAR; PG8_SCHED;
            PG8_LDA(At, 1, 1); PG8_STAGE(PG8_SB(1, 0), b3, voffB); PG8_STAGE(PG8_SB(1, 1), b3 + hstepB, voffB); PG8_STAGE(PG8_SA(1, 0), a3, offC[0]);
            PG8_WAIT_V(8); PG8_WAIT_L(0); PG8_BAR; PG8_MMA(1, 0, At, B0); PG8_MMA(1, 1, At, B1); PG8_BAR; PG8_SCHED;
        }
        if (wr == 0) PG8_BAR;
        E(acc, cur, wr, wc, fr, fq); S.done(cur);
        if (!has_next) break;
#pragma unroll
        for (int a = 0; a < 2; ++a)
#pragma unroll
            for (int b = 0; b < 2; ++b)
#pragma unroll
                for (int m = 0; m < 4; ++m)
#pragma unroll
                    for (int n = 0; n < 2; ++n) acc[a][b][m][n] = (f32x4){0.f, 0.f, 0.f, 0.f};
        cur = nxt; cB = nB; ++ui;
        if (wr == 1) PG8_BAR;
    }
    PG8_WAIT_V(0);
    PG8_BAR;
#undef PG8_ROWS
#undef PG8_SA
#undef PG8_SB
#undef PG8_STAGE
#undef PG8_LDA
#undef PG8_LDB
#undef PG8_MMA
#undef PG8_WAIT_V
#undef PG8_WAIT_L
#undef PG8_BAR
#undef PG8_SCHED
}
}

constexpr int T = 8192, D = 2048, NL = 2, BW = 512, ZC = 14336, INC = 14352;
constexpr int NE = 64, NEX = 65  , ED = 512;
constexpr int HK = NEX * ED;
constexpr float ALPHA = 1.41421356237f;
constexpr float LN_EPS = 1e-5f;
constexpr int ZC_SBQ = 0, ZC_SBK = 512, ZC_SBV = 1024, ZC_GMU = 1536, ZC_GMV = 2048, ZC_GDN = 2560, ZC_GDNG = 4096,
              ZC_MLQ = 4608, ZC_MLK = 4864, ZC_MLV = 5120, ZC_MLO = 5632, ZC_GATE = 6144;

#define GAS __attribute__((address_space(1)))
#define LAS __attribute__((address_space(3)))
typedef unsigned short bf16;
typedef unsigned v4u __attribute__((ext_vector_type(4)));
typedef unsigned v2u __attribute__((ext_vector_type(2)));
typedef float v4f __attribute__((ext_vector_type(4)));
typedef float v2f __attribute__((ext_vector_type(2)));
#define LDS_WAIT() asm volatile("s_waitcnt lgkmcnt(0)" ::: "memory")
#define LDS_BAR() do { asm volatile("s_waitcnt lgkmcnt(0)" ::: "memory"); __builtin_amdgcn_s_barrier(); asm volatile("" ::: "memory"); } while (0)

constexpr size_t MiB = 1u << 20;
constexpr size_t WS_CTL = 0, CTL_ZERO_BYTES = 1 * MiB;
constexpr size_t WS_WIN = 2 * MiB, WS_WBR = 58 * MiB, WS_WOUT = 66 * MiB, WS_WUP = 74 * MiB, WS_WDN = 334 * MiB;
constexpr size_t WS_XB = 464 * MiB, WS_SMALL = 496 * MiB, WS_EG = 497 * MiB, WS_BETA = WS_EG + 256 * 1024, WS_COMB = 498 * MiB;
constexpr size_t WS_Z = 500 * MiB, WS_GQ = 724 * MiB, WS_GK = 740 * MiB, WS_GV = 756 * MiB, WS_GO = 772 * MiB, WS_HO = 788 * MiB;
constexpr size_t WS_BR = 804 * MiB, WS_MTMP = 836 * MiB, WS_MSUM = 900 * MiB, WS_Y = 932 * MiB, WS_X1 = 996 * MiB, WS_X1B = 1060 * MiB;
constexpr size_t WS_XCUR = 1092 * MiB, WS_HB = 1156 * MiB, WS_YEXP = 1236 * MiB, WS_LIST = 1524 * MiB, WS_WL = 1526 * MiB, WS_SLOT = 1528 * MiB, WS_MQ = 1530 * MiB, WS_MS = 1534 * MiB, WS_MK = 1538 * MiB, WS_MV = 1542 * MiB, WS_MFL = 1552 * MiB, WS_HDEN = WS_MFL + 65536, WS_VT = 1553 * MiB, WS_END = 1561 * MiB;
constexpr size_t WS_GU = WS_GQ, WS_GNW = WS_GK, WS_GQG = WS_GK + 8 * MiB, WS_GKT = WS_GV, WS_GAT = WS_GV + 8 * MiB, WS_GDL = WS_GV + 12 * MiB;
constexpr int HROWS = 73728;
static_assert(WS_HB + (size_t)HROWS * ED * 2 <= WS_YEXP && WS_YEXP + (size_t)HROWS * D * 2 <= WS_LIST, "ws map (moe)");
static_assert(WS_WIN + (size_t)ZC * D * 2 <= WS_WBR && WS_WUP + (size_t)NEX * 1024 * D * 2 <= WS_WDN && WS_WDN + (size_t)D * HK * 2 <= WS_XB, "ws map (weights)");
static_assert(WS_Z + (size_t)T * ZC * 2 <= WS_GQ, "ws map (acts)");
constexpr int CW_BAR = 4096, CW_CNT = 16384;
constexpr int TAB_OFF = 131072 + 1024;
constexpr int LDS_BYTES = 163840, MISC_OFF = 131072 + 320;

__device__ __forceinline__ float bflo(unsigned w) { return __uint_as_float(w << 16); }
__device__ __forceinline__ float bfhi(unsigned w) { return __uint_as_float(w & 0xffff0000u); }
__device__ __forceinline__ unsigned f2bf(float f) { unsigned u = __float_as_uint(f); return (u + 0x7fffu + ((u >> 16) & 1u)) >> 16; }
__device__ __forceinline__ unsigned pk2(float lo, float hi) { return f2bf(lo) | (f2bf(hi) << 16); }
template <int CTRL> __device__ __forceinline__ float dpp(float x) { return __builtin_bit_cast(float, __builtin_amdgcn_mov_dpp(__builtin_bit_cast(int, x), CTRL, 0xf, 0xf, true)); }
__device__ __forceinline__ float sum4(float x) { x += dpp<0xB1>(x); x += dpp<0x4E>(x); return x; }
__device__ __forceinline__ float sum8(float x) { x = sum4(x); x += dpp<0x141>(x); return x; }
__device__ __forceinline__ float sum16(float x) { x = sum8(x); x += dpp<0x140>(x); return x; }
__device__ __forceinline__ float wave_sum(float x) { x = sum16(x); x += __shfl_xor(x, 16); x += __shfl_xor(x, 32); return x; }
__device__ __forceinline__ float max8(float x) { x = fmaxf(x, dpp<0xB1>(x)); x = fmaxf(x, dpp<0x4E>(x)); x = fmaxf(x, dpp<0x141>(x)); return x; }
__device__ __forceinline__ float min8(float x) { x = fminf(x, dpp<0xB1>(x)); x = fminf(x, dpp<0x4E>(x)); x = fminf(x, dpp<0x141>(x)); return x; }
__device__ __forceinline__ float wave_scan_incl(float v) {
    v += __builtin_bit_cast(float, __builtin_amdgcn_update_dpp(0, __builtin_bit_cast(int, v), 0x111, 0xf, 0xf, true));
    v += __builtin_bit_cast(float, __builtin_amdgcn_update_dpp(0, __builtin_bit_cast(int, v), 0x112, 0xf, 0xf, true));
    v += __builtin_bit_cast(float, __builtin_amdgcn_update_dpp(0, __builtin_bit_cast(int, v), 0x114, 0xf, 0xf, true));
    v += __builtin_bit_cast(float, __builtin_amdgcn_update_dpp(0, __builtin_bit_cast(int, v), 0x118, 0xf, 0xf, true));
    v += __builtin_bit_cast(float, __builtin_amdgcn_update_dpp(0, __builtin_bit_cast(int, v), 0x142, 0xa, 0xf, false));
    v += __builtin_bit_cast(float, __builtin_amdgcn_update_dpp(0, __builtin_bit_cast(int, v), 0x143, 0xc, 0xf, false));
    return v;
}
__device__ __forceinline__ float sigmoidf_(float x) { return 1.f / (1.f + __expf(-x)); }
__device__ __forceinline__ float siluf_(float x) { return x / (1.f + __expf(-x)); }
__device__ __forceinline__ float softplusf_(float x) { return fmaxf(x, 0.f) + __logf(1.f + __expf(-fabsf(x))); }
__device__ __forceinline__ float gelu_tanh(float x) { const float y = 0.7978845608f * (x + 0.044715f * x * x * x); const float t = 1.f - 2.f / (__expf(2.f * y) + 1.f); return 0.5f * x * (1.f + t); }
__device__ __forceinline__ void unpack8(const v4u r, float (&f)[8]) { f[0] = bflo(r.x); f[1] = bfhi(r.x); f[2] = bflo(r.y); f[3] = bfhi(r.y); f[4] = bflo(r.z); f[5] = bfhi(r.z); f[6] = bflo(r.w); f[7] = bfhi(r.w); }
#define XB_TMO      128
#define XB_XCNT(j)  (256  + 64 * (j))
#define XB_XSUB(j)  (1280 + 64 * (j))
#define XB_XGEN(j)  (2304 + 64 * (j))
#define XB_TOP      3328
#define XB_TOPGEN   3392
#define XCD_BAR_WORDS 3456
#define XB_SPIN_CAP (1u << 18)

__device__ __forceinline__ unsigned xb_ld(unsigned* p)              { return __hip_atomic_load(p, __ATOMIC_RELAXED, __HIP_MEMORY_SCOPE_AGENT); }
__device__ __forceinline__ unsigned xb_add(unsigned* p, unsigned v) { return __hip_atomic_fetch_add(p, v, __ATOMIC_RELAXED, __HIP_MEMORY_SCOPE_AGENT); }
__device__ __forceinline__ unsigned xb_xcc_id() { return (unsigned)__builtin_amdgcn_s_getreg((3 << 11) | 20) & 0xFu; }
#define XB_SPIN(cond, bar) do { unsigned _sp = 0; while (cond) { __builtin_amdgcn_s_sleep(1); \
    if ((++_sp & 255u) == 0u) { if (xb_ld(&(bar)[XB_TMO])) break; if (_sp > XB_SPIN_CAP) { atomicAdd(&(bar)[XB_TMO], 1u); break; } } } } while (0)

struct XcdBarrier {
    unsigned* bar; unsigned x;
    volatile LAS unsigned* st;
};

__device__ __forceinline__ XcdBarrier xcd_barrier_post(unsigned* bar, volatile LAS unsigned* st) {
    XcdBarrier b; b.bar = bar; b.x = xb_xcc_id(); b.st = st;
    if (threadIdx.x == 0) (void)xb_add(&bar[XB_XCNT(b.x)], 1u);
    return b;
}
__device__ __forceinline__ void xcd_barrier_complete(unsigned* bar, unsigned x, unsigned& nloc, unsigned& nx) {
    const unsigned G = gridDim.x * gridDim.y * gridDim.z;
    unsigned sum, cnt, mine, sp = 0u;
    for (;;) {
        sum = 0u; cnt = 0u; mine = 0u;
#pragma unroll
        for (unsigned j = 0; j < 16; ++j) { const unsigned c = xb_ld(&bar[XB_XCNT(j)]); sum += c; cnt += (c > 0u) ? 1u : 0u; mine = (j == x) ? c : mine; }
        if (sum == G) break;
        __builtin_amdgcn_s_sleep(1);
        if ((++sp & 255u) == 0u) { if (xb_ld(&bar[XB_TMO])) break; if (sp > XB_SPIN_CAP) { atomicAdd(&bar[XB_TMO], 1u); break; } }
    }
    nloc = mine > 0u ? mine : 1u; nx = cnt > 0u ? cnt : 1u;
}

__device__ __forceinline__ void xcd_barrier(const XcdBarrier& b) {
    asm volatile("s_waitcnt vmcnt(0)" ::: "memory");
    __syncthreads();
    if (threadIdx.x == 0) {
        unsigned* bar = b.bar;
        __builtin_amdgcn_s_waitcnt(0);
        unsigned nloc = b.st[0], nx = b.st[1];
        if (nloc == 0u) { xcd_barrier_complete(bar, b.x, nloc, nx); b.st[0] = nloc; b.st[1] = nx; }
        const unsigned old = xb_add(&bar[XB_XSUB(b.x)], 1u);
        const unsigned gen = old / nloc;
        if (old + 1u == (gen + 1u) * nloc) {
            __builtin_amdgcn_fence(__ATOMIC_RELEASE, "agent");
            asm volatile("s_waitcnt vmcnt(0)" ::: "memory");
            const unsigned og = xb_add(&bar[XB_TOP], 1u);
            const unsigned tg = og / nx;
            if (og + 1u == (tg + 1u) * nx) xb_add(&bar[XB_TOPGEN], 1u);
            else XB_SPIN(xb_ld(&bar[XB_TOPGEN]) == tg, bar);
            __builtin_amdgcn_fence(__ATOMIC_ACQUIRE, "agent");
            xb_add(&bar[XB_XGEN(b.x)], 1u);
            asm volatile("s_waitcnt vmcnt(0)" ::: "memory");
        } else {
            XB_SPIN(xb_ld(&bar[XB_XGEN(b.x)]) == gen, bar);
            __builtin_amdgcn_fence(__ATOMIC_ACQUIRE, "agent");
            asm volatile("s_waitcnt vmcnt(0)" ::: "memory");
        }
    }
    __syncthreads();
}

struct Params { const float* in[27]; float* out; unsigned char* ws; int ph_lo, ph_hi; };
enum { I_X = 0, I_WIN, I_GMNG, I_GMNB, I_GMWS, I_GMBS, I_CONVW, I_ALOG, I_DTB, I_GDNNG, I_MLIB, I_MLFB, I_MLNG, I_WBR, I_WOUT, I_LN1G, I_LN1B,
       I_WR, I_RB, I_WG, I_WU, I_WD, I_SG, I_SU, I_SD, I_LN2G, I_LN2B };

using pg8::f32x4; using pg8::u32x4; using pg8::Unit; using pg8::HALF; using pg8::BM;

struct MergeOrder {
    int G, c;
    __device__ bool next(int i, Unit& u) const {
        const long L = (long)(i >> 2) * G + c; if (L >= 256) return false;
        const int g = i & 3; int wgid = (int)L; { const int q = 256 / 8, xcd = wgid % 8, off = wgid / 8; wgid = xcd * q + off; }
        const int nN = 8, nig = 8 * nN, gid = wgid / nig, fm = gid * 8; const int pm = fm + ((wgid % nig) % 8), pn = (wgid % nig) / 8;
        u.pm = g * 32 + pm; u.pn = g * 8 + pn; return true;
    }
    __device__ __forceinline__ void a_ready(const Unit&) const {}
    __device__ __forceinline__ void done(const Unit&) const {}
};
struct EpiMerge {
    static constexpr bool PERM = true, AFTER_DRAIN = false;
    const bf16* Z; float* tmp; bf16* msum;
    __device__ __forceinline__ void operator()(const f32x4 (&acc)[2][2][4][2], const Unit& u, int wr, int wc, int fr, int fq) const {
        const int g = u.pm >> 5, pm = u.pm & 31, pn = u.pn & 7;
        const int row0 = pm * BM + wr * 64 + fr, col0 = pn * BM + wc * 32 + 8 * fq;
#pragma unroll
        for (int ai = 0; ai < 2; ++ai)
#pragma unroll
            for (int m = 0; m < 4; ++m) { const size_t row = (size_t)(row0 + ai * HALF + m * 16);
#pragma unroll
                for (int bj = 0; bj < 2; ++bj) { const int col = col0 + bj * HALF;
                    const v4u gr = *(const v4u*)(Z + row * ZC + ZC_GATE + g * D + col); float gl[8]; unpack8(gr, gl);
                    float* tp = tmp + row * D + col; f32x4 v0 = acc[ai][bj][m][0], v1 = acc[ai][bj][m][1];
#pragma unroll
                    for (int j = 0; j < 4; ++j) { v0[j] *= sigmoidf_(gl[j]); v1[j] *= sigmoidf_(gl[4 + j]); }
                    if (g > 0) { v0 += *(const f32x4*)tp; v1 += *(const f32x4*)(tp + 4); }
                    if (g < 3) { *(f32x4*)tp = v0; *(f32x4*)(tp + 4) = v1; }
                    else { u32x4 w; w.x = pk2(v0[0], v0[1]); w.y = pk2(v0[2], v0[3]); w.z = pk2(v1[0], v1[1]); w.w = pk2(v1[2], v1[3]); *(u32x4*)(msum + row * D + col) = w; } }
                asm volatile("" ::: "memory"); }
    }
};
struct EpiResid {
    static constexpr bool PERM = false, AFTER_DRAIN = false;
    const float* X; float* Y;
    __device__ __forceinline__ void operator()(const f32x4 (&acc)[2][2][4][2], const Unit& u, int wr, int wc, int fr, int fq) const {
        const int row0 = u.pm * BM + wr * 64 + fr, col0 = u.pn * BM + wc * 32 + 4 * fq;
#pragma unroll
        for (int ai = 0; ai < 2; ++ai)
#pragma unroll
            for (int m = 0; m < 4; ++m) { const size_t off = (size_t)(row0 + ai * HALF + m * 16) * D + col0;
#pragma unroll
                for (int bj = 0; bj < 2; ++bj)
#pragma unroll
                    for (int n = 0; n < 2; ++n) { const f32x4 xv = *(const f32x4*)(X + off + bj * HALF + n * 16); *(f32x4*)(Y + off + bj * HALF + n * 16) = xv * ALPHA + acc[ai][bj][m][n]; } }
    }
};
struct MoeTab {
    LAS int* t; LAS unsigned short* tok; LAS float* wt; LAS unsigned char* mte;
    __device__ __forceinline__ MoeTab(LAS unsigned char* lds) : t((LAS int*)(lds + TAB_OFF)), tok((LAS unsigned short*)(lds + TAB_OFF + 1024)), wt((LAS float*)(lds + TAB_OFF + 5120)), mte((LAS unsigned char*)(lds + TAB_OFF + 13312)) {}
};
__device__ __forceinline__ void moe_tables(const MoeTab& M, const unsigned* cnt  , int tid, int lane, int wave) {
    __syncthreads();
    if (wave == 0) { const int c = (int)cnt[64 * lane]; const int tiles = (c + 255) >> 8; const float incl = wave_scan_incl((float)tiles);
        M.t[80 + lane] = c; M.t[lane] = (int)incl - tiles; if (lane == 63) { M.t[64] = (int)incl; M.t[65] = (int)incl + T / 256; M.t[80 + 64] = T; } }
    __syncthreads();
    const int Mt = M.t[65];
    for (int mt = tid; mt < Mt; mt += 512) { int e = 0;
        for (int k = 1; k <= 64; ++k) e = (M.t[k] <= mt) ? k : e;
        M.mte[mt] = (unsigned char)e; }
    __syncthreads();
}
struct UpOrder {
    MoeTab M; int n;
    __device__ __forceinline__ bool next(int i, Unit& u) const { if (i >= n) return false; u.pm = M.t[168 + i]; u.pn = M.t[176 + i]; u.aux = i; return true; }
    __device__ __forceinline__ int row_token(int i, int r) const { return (int)M.tok[i * 256 + r]; }
    __device__ __forceinline__ void a_ready(const Unit&) const {}
    __device__ __forceinline__ void done(const Unit&) const {}
};
__device__ __forceinline__ int up_order_build(const MoeTab& M, const int* LIST, const float* WL, int wg, int G, int tid) {
    const int U = 4 * M.t[65];
    if (tid < 8) { const int L = tid * G + wg; if (L < U) { const int mt = L >> 2, q = L & 3, e = M.mte[mt]; M.t[168 + tid] = mt; M.t[176 + tid] = e * 4 + q; M.t[184 + tid] = e; M.t[192 + tid] = mt - M.t[e]; } }
    int n = 0;
#pragma unroll
    for (int i = 0; i < 8; ++i) n += (i * G + wg < U) ? 1 : 0;
    __syncthreads();
    for (int idx = tid; idx < n * 256; idx += 512) { const int i = idx >> 8, r = idx & 255, e = M.t[184 + i], li = M.t[192 + i] * 256 + r;
        int tk = 0; float w = 0.f;
        if (e < NE) { if (li < M.t[80 + e]) { tk = LIST[e * T + li]; w = WL[e * T + li]; } } else { tk = li; w = 1.f; }
        M.tok[idx] = (unsigned short)tk; M.wt[idx] = w; }
    __syncthreads();
    return n;
}
struct EpiGluSparse {
    static constexpr bool PERM = true, AFTER_DRAIN = false;
    LAS const float* wt; bf16* H;
    __device__ __forceinline__ void operator()(const f32x4 (&acc)[2][2][4][2], const Unit& u, int wr, int wc, int fr, int fq) const {
        const int q = u.pn & 3; const int rl0 = wr * 64 + fr, col0 = q * 128 + wc * 32 + 8 * fq;
#pragma unroll
        for (int ai = 0; ai < 2; ++ai)
#pragma unroll
            for (int m = 0; m < 4; ++m) { const int rl = rl0 + ai * HALF + m * 16; const float c = wt[u.aux * 256 + rl]; float h[8];
#pragma unroll
                for (int n = 0; n < 2; ++n)
#pragma unroll
                    for (int j = 0; j < 4; ++j) h[4 * n + j] = siluf_(acc[ai][0][m][n][j]) * acc[ai][1][m][n][j] * c;
                u32x4 w; w.x = pk2(h[0], h[1]); w.y = pk2(h[2], h[3]); w.z = pk2(h[4], h[5]); w.w = pk2(h[6], h[7]);
                *(u32x4*)(H + ((size_t)u.pm * 256 + rl) * ED + col0) = w; }
    }
};
struct DownOrder {
    MoeTab M; int G, c, U;
    __device__ __forceinline__ bool next(int i, Unit& u) const { const int L = i * G + c; if (L >= U) return false; const int mt = L >> 3; u.pm = mt; u.pn = (int)M.mte[mt] * 8 + (L & 7); u.aux = 0; return true; }
    __device__ __forceinline__ void a_ready(const Unit&) const {}
    __device__ __forceinline__ void done(const Unit&) const {}
};
struct EpiYexp {
    static constexpr bool PERM = true, AFTER_DRAIN = false;
    bf16* Y;
    __device__ __forceinline__ void operator()(const f32x4 (&acc)[2][2][4][2], const Unit& u, int wr, int wc, int fr, int fq) const {
        const int row0 = u.pm * BM + wr * 64 + fr, col0 = (u.pn & 7) * BM + wc * 32 + 8 * fq;
#pragma unroll
        for (int ai = 0; ai < 2; ++ai)
#pragma unroll
            for (int m = 0; m < 4; ++m) { bf16* rowp = Y + (size_t)(row0 + ai * HALF + m * 16) * D + col0;
#pragma unroll
                for (int bj = 0; bj < 2; ++bj) { const f32x4 v0 = acc[ai][bj][m][0], v1 = acc[ai][bj][m][1];
                    u32x4 w; w.x = pk2(v0[0], v0[1]); w.y = pk2(v0[2], v0[3]); w.z = pk2(v1[0], v1[1]); w.w = pk2(v1[2], v1[3]); *(u32x4*)(rowp + bj * HALF) = w; } }
    }
};

__device__ __forceinline__ void tr_item(const float* src, size_t sld, bf16* dst, size_t dld, LAS float* scr, int lane) {
    { const int r8 = lane >> 3, c4 = lane & 7; v4f v[8];
#pragma unroll
      for (int i = 0; i < 8; ++i) v[i] = *(const v4f*)(src + (size_t)(8 * i + r8) * sld + 4 * c4);
#pragma unroll
      for (int i = 0; i < 8; ++i) { LAS float* d = scr + (8 * i + r8) * 33 + 4 * c4; d[0] = v[i].x; d[1] = v[i].y; d[2] = v[i].z; d[3] = v[i].w; } }
    LDS_WAIT(); asm volatile("" ::: "memory");
    const int c = lane & 7;
#pragma unroll
    for (int j = 0; j < 4; ++j) { const int n = (lane >> 3) + 8 * j; const LAS float* s = scr + (8 * c) * 33 + n;
        v4u o; o.x = pk2(s[0 * 33], s[1 * 33]); o.y = pk2(s[2 * 33], s[3 * 33]); o.z = pk2(s[4 * 33], s[5 * 33]); o.w = pk2(s[6 * 33], s[7 * 33]);
        *(v4u*)(dst + (size_t)n * dld + 8 * c) = o; }
    LDS_WAIT(); asm volatile("" ::: "memory");
}
template <int PART> __device__ __forceinline__ void phase_convert(const Params& p, int l, LAS unsigned char* lds, int gw, int NGW, int wave, int lane) {
    unsigned char* ws = p.ws;
    const float* w_in = p.in[I_WIN] + (size_t)l * D * INC; const float* w_br = p.in[I_WBR] + (size_t)l * 4 * BW * D; const float* w_out = p.in[I_WOUT] + (size_t)l * D * D;
    const float* w_g = p.in[I_WG] + (size_t)l * NE * D * ED; const float* w_u = p.in[I_WU] + (size_t)l * NE * D * ED; const float* w_d = p.in[I_WD] + (size_t)l * NE * ED * D;
    const float* s_g = p.in[I_SG] + (size_t)l * D * ED; const float* s_u = p.in[I_SU] + (size_t)l * D * ED; const float* s_d = p.in[I_SD] + (size_t)l * ED * D;
    bf16* WIN = (bf16*)(ws + WS_WIN); bf16* WBR = (bf16*)(ws + WS_WBR); bf16* WOUT = (bf16*)(ws + WS_WOUT); bf16* WUP = (bf16*)(ws + WS_WUP); bf16* WDN = (bf16*)(ws + WS_WDN);
    LAS float* scr = (LAS float*)(lds + wave * 16384);
    constexpr int N_IN = (ZC / 32) * (D / 64), N_BR = 4 * (BW / 64) * (D / 32), N_OUT = (D / 64) * (D / 32), N_UP = NEX * 2 * (D / 64) * (ED / 32), N_DN = NEX * (ED / 64) * (D / 32);
    constexpr int NSMALL = N_IN + N_BR + N_OUT, NITEMS = (PART == 0) ? NSMALL : (N_UP + N_DN);
    for (int it = gw; it < NITEMS; it += NGW) {
        int r = it + (PART == 0 ? 0 : NSMALL);
        if (r < N_IN) { const int kb = r / (ZC / 32), n0 = (r % (ZC / 32)) * 32, k0 = kb * 64; const int sc = n0 + (n0 >= ZC_GATE ? 16 : (n0 >= ZC_MLQ ? 8 : 0));
            tr_item(w_in + (size_t)k0 * INC + sc, INC, WIN + (size_t)n0 * D + k0, D, scr, lane); continue; } r -= N_IN;
        if (r < N_BR) { const int g = r / 512, rr = r % 512, k0 = (rr / 64) * 64, n0 = (rr % 64) * 32;
            tr_item(w_br + ((size_t)g * BW + k0) * D + n0, D, WBR + ((size_t)g * D + n0) * BW + k0, BW, scr, lane); continue; } r -= N_BR;
        if (r < N_OUT) { const int k0 = (r / 64) * 64, n0 = (r % 64) * 32;
            tr_item(w_out + (size_t)k0 * D + n0, D, WOUT + (size_t)n0 * D + k0, D, scr, lane); continue; } r -= N_OUT;
        if (r < N_UP) { const int e = r / 1024, rr = r % 1024, mat = rr / 512, r2 = rr % 512, k0 = (r2 / 16) * 64, n0 = (r2 % 16) * 32;
            const float* sb = (e < NE) ? ((mat ? w_u : w_g) + (size_t)e * D * ED) : (mat ? s_u : s_g);
            const int drow = e * 1024 + (n0 / 128) * 256 + mat * 128 + (n0 % 128);
            tr_item(sb + (size_t)k0 * ED + n0, ED, WUP + (size_t)drow * D + k0, D, scr, lane); continue; } r -= N_UP;
        { const int e = r / 512, rr = r % 512, k0 = (rr / 64) * 64, n0 = (rr % 64) * 32;
            const float* sb = (e < NE) ? (w_d + (size_t)e * ED * D) : s_d;
            tr_item(sb + (size_t)k0 * D + n0, D, WDN + ((size_t)e * D + n0) * ED + k0, ED, scr, lane); }
    }
}
__device__ __forceinline__ void phase_xprep(const Params& p, int l, const float* xin, LAS unsigned char* lds, int gw, int NGW, int tid, int lane) {
    const float* w_in = p.in[I_WIN] + (size_t)l * D * INC; LAS float* wsm = (LAS float*)lds;
    __syncthreads();
    for (int idx = tid; idx < D * 16; idx += 512) { const int d = idx >> 4, c = idx & 15; wsm[c * D + d] = w_in[(size_t)d * INC + (c < 8 ? 4608 + c : 6152 + (c - 8))]; }
    __syncthreads();
    bf16* XB = (bf16*)(p.ws + WS_XB); float* SMALL = (float*)(p.ws + WS_SMALL);
    for (int m = gw; m < T; m += NGW) {
        const v4f* xr = (const v4f*)(xin + (size_t)m * D) + lane; v4f v[8];
#pragma unroll
        for (int j = 0; j < 8; ++j) v[j] = xr[64 * j];
        v2u* xo = (v2u*)(XB + (size_t)m * D) + lane;
#pragma unroll
        for (int j = 0; j < 8; ++j) { v2u o; o.x = pk2(v[j].x, v[j].y); o.y = pk2(v[j].z, v[j].w); xo[64 * j] = o; }
        float res = 0.f;
#pragma unroll 1
        for (int c = 0; c < 16; ++c) { float a = 0.f;
#pragma unroll
            for (int j = 0; j < 8; ++j) { const v4f w = *(const LAS v4f*)(wsm + c * D + 4 * lane + 256 * j); a += v[j].x * w.x + v[j].y * w.y + v[j].z * w.z + v[j].w * w.w; }
            a = wave_sum(a); if (lane == c) res = a; }
        if (lane < 16) SMALL[(size_t)m * 16 + lane] = res;
    }
    __syncthreads();
}


typedef short bf16x8_t __attribute__((ext_vector_type(8)));
__device__ __forceinline__ void ml_pre_item(const Params& p, int l, LAS unsigned char* lds, int item, int tid, int wave, int lane) {
    const int h = item & 3, n = item >> 2; const size_t t0 = (size_t)n * 64;
    const bf16* Z = (const bf16*)(p.ws + WS_Z); const float* SMALL = (const float*)(p.ws + WS_SMALL);
    bf16* MQ = (bf16*)(p.ws + WS_MQ) + (size_t)item * 4096; bf16* MS = (bf16*)(p.ws + WS_MS) + (size_t)item * 4096; bf16* MK = (bf16*)(p.ws + WS_MK) + (size_t)item * 4096;
    bf16* MV = (bf16*)(p.ws + WS_MV) + (size_t)item * 9216; float* MFL = (float*)(p.ws + WS_MFL);
    LAS float* qs = (LAS float*)lds;
    LAS float* ks = qs + 64 * 65;
    LAS float* bs = ks + 64 * 65;
    LAS unsigned short* vs = (LAS unsigned short*)(bs + 128);
    { const int tk = tid >> 3, c8 = tid & 7; float f[8];
      unpack8(*(const v4u*)(Z + (t0 + tk) * ZC + ZC_MLQ + h * 64 + 8 * c8), f);
#pragma unroll
      for (int i = 0; i < 8; ++i) qs[tk * 65 + 8 * c8 + i] = f[i];
      unpack8(*(const v4u*)(Z + (t0 + tk) * ZC + ZC_MLK + h * 64 + 8 * c8), f);
#pragma unroll
      for (int i = 0; i < 8; ++i) ks[tk * 65 + 8 * c8 + i] = f[i]; }
#pragma unroll
    for (int r = 0; r < 2; ++r) { const int idx = tid + 512 * r, tk = idx >> 4, c8 = idx & 15;
        *(LAS v4u*)(vs + tk * 136 + 8 * c8) = *(const v4u*)(Z + (t0 + tk) * ZC + ZC_MLV + h * 128 + 8 * c8); }
    if (wave == 0) { const float fp = SMALL[(t0 + lane) * 16 + 12 + h] + p.in[I_MLFB][l * 4 + h]; const float lf = -softplusf_(-fp);
        bs[lane] = wave_scan_incl(lf); bs[64 + lane] = SMALL[(t0 + lane) * 16 + 8 + h] + p.in[I_MLIB][l * 4 + h]; }
    __syncthreads();
    const float blast = bs[63];
    { const int i = tid >> 3, jb = tid & 7; const float bi = bs[i];
      { const float e = __expf(bi) * 0.125f; float o[8];
#pragma unroll
        for (int x = 0; x < 8; ++x) o[x] = qs[i * 65 + 8 * jb + x] * e;
        v4u w; w.x = pk2(o[0], o[1]); w.y = pk2(o[2], o[3]); w.z = pk2(o[4], o[5]); w.w = pk2(o[6], o[7]); *(v4u*)(MQ + i * 64 + 8 * jb) = w; }
      { float d[8];
#pragma unroll
        for (int x = 0; x < 8; ++x) d[x] = 0.f;
        if (8 * jb <= i) {
            for (int dd = 0; dd < 64; ++dd) { const float qv = qs[i * 65 + dd];
#pragma unroll
                for (int x = 0; x < 8; ++x) d[x] += qv * ks[(8 * jb + x) * 65 + dd]; }
#pragma unroll
            for (int x = 0; x < 8; ++x) { const int j = 8 * jb + x; d[x] = (j <= i) ? __expf(bi - bs[j] + bs[64 + j]) * d[x] * 0.125f : 0.f; } }
        v4u w; w.x = pk2(d[0], d[1]); w.y = pk2(d[2], d[3]); w.z = pk2(d[4], d[5]); w.w = pk2(d[6], d[7]); *(v4u*)(MS + i * 64 + 8 * jb) = w; }
      { float o[8];
#pragma unroll
        for (int x = 0; x < 8; ++x) { const int j = 8 * jb + x; o[x] = ks[j * 65 + i] * __expf(blast - bs[j] + bs[64 + j]); }
        v4u w; w.x = pk2(o[0], o[1]); w.y = pk2(o[2], o[3]); w.z = pk2(o[4], o[5]); w.w = pk2(o[6], o[7]); *(v4u*)(MK + i * 64 + 8 * jb) = w; }
    }
    { const int c = tid >> 2, jq = tid & 3; unsigned w[8];
#pragma unroll
      for (int x = 0; x < 8; ++x) w[x] = (unsigned)vs[(16 * jq + 2 * x) * 136 + c] | ((unsigned)vs[(16 * jq + 2 * x + 1) * 136 + c] << 16);
      *(v4u*)(MV + c * 64 + 16 * jq) = (v4u){w[0], w[1], w[2], w[3]}; *(v4u*)(MV + c * 64 + 16 * jq + 8) = (v4u){w[4], w[5], w[6], w[7]};
      if (tid < 64) { const int c2 = 128 + (tid >> 2); const unsigned one = (c2 == 128) ? 0x3F803F80u : 0u;
          *(v4u*)(MV + c2 * 64 + 16 * jq) = (v4u){one, one, one, one}; *(v4u*)(MV + c2 * 64 + 16 * jq + 8) = (v4u){one, one, one, one}; } }
    if (tid == 0) MFL[item] = __expf(blast);
    __syncthreads();
}
struct MlFrags { bf16x8_t q[2], s[2], kt[2], vt[2]; float fl; };
__device__ __forceinline__ void ml_load(MlFrags& F, const Params& p, int item, int offA, int offV) {
    const bf16* MQ = (const bf16*)(p.ws + WS_MQ) + (size_t)item * 4096; const bf16* MS = (const bf16*)(p.ws + WS_MS) + (size_t)item * 4096; const bf16* MK = (const bf16*)(p.ws + WS_MK) + (size_t)item * 4096;
    const bf16* MV = (const bf16*)(p.ws + WS_MV) + (size_t)item * 9216;
#pragma unroll
    for (int ks = 0; ks < 2; ++ks) { F.q[ks] = *(const bf16x8_t*)(MQ + offA + 32 * ks); F.s[ks] = *(const bf16x8_t*)(MS + offA + 32 * ks); F.kt[ks] = *(const bf16x8_t*)(MK + offA + 32 * ks); F.vt[ks] = *(const bf16x8_t*)(MV + offV + 32 * ks); }
    F.fl = ((const float*)(p.ws + WS_MFL))[item];
}
__device__ __forceinline__ void ml_seq(const Params& p, LAS unsigned char* lds, int wgi, int wave, int lane) {
    const int u = wgi * 2 + (wave >> 2), wi = wave & 3, h = u / 9, sl = u % 9, g = lane >> 4, c = lane & 15;
    LAS unsigned short* CT = (LAS unsigned short*)(lds + (wave >> 2) * 4096);
    float* HO = (float*)(p.ws + WS_HO); float* HDEN = (float*)(p.ws + WS_HDEN);
    const int offA = (16 * wi + c) * 64 + 8 * g, offV = (16 * sl + c) * 64 + 8 * g;
    *(LAS v2u*)(CT + c * 64 + 16 * wi + 4 * g) = (v2u){0u, 0u};
    pg8::f32x4 Cacc = {0.f, 0.f, 0.f, 0.f};
    __syncthreads();
    MlFrags F0, F1;
    ml_load(F0, p, h, offA, offV);
#define ML_STEP(F, n_) do { const int cur = (n_) & 1; \
        const bf16x8_t c0 = *(const LAS bf16x8_t*)(CT + cur * 1024 + c * 64 + 8 * g), c1 = *(const LAS bf16x8_t*)(CT + cur * 1024 + c * 64 + 32 + 8 * g); \
        pg8::f32x4 num = {0.f, 0.f, 0.f, 0.f}; \
        num = __builtin_amdgcn_mfma_f32_16x16x32_bf16(F.q[0], c0, num, 0, 0, 0); num = __builtin_amdgcn_mfma_f32_16x16x32_bf16(F.q[1], c1, num, 0, 0, 0); \
        num = __builtin_amdgcn_mfma_f32_16x16x32_bf16(F.s[0], F.vt[0], num, 0, 0, 0); num = __builtin_amdgcn_mfma_f32_16x16x32_bf16(F.s[1], F.vt[1], num, 0, 0, 0); \
        Cacc = Cacc * F.fl; \
        Cacc = __builtin_amdgcn_mfma_f32_16x16x32_bf16(F.kt[0], F.vt[0], Cacc, 0, 0, 0); Cacc = __builtin_amdgcn_mfma_f32_16x16x32_bf16(F.kt[1], F.vt[1], Cacc, 0, 0, 0); \
        { v2u w; w.x = pk2(Cacc[0], Cacc[1]); w.y = pk2(Cacc[2], Cacc[3]); *(LAS v2u*)(CT + (cur ^ 1) * 1024 + c * 64 + 16 * wi + 4 * g) = w; } \
        { const size_t tb = (size_t)(n_) * 64 + 16 * wi + 4 * g; \
          if (sl < 8) { _Pragma("unroll") for (int r = 0; r < 4; ++r) HO[(tb + r) * BW + h * 128 + 16 * sl + c] = num[r]; } \
          else if (c == 0) { _Pragma("unroll") for (int r = 0; r < 4; ++r) HDEN[(tb + r) * 4 + h] = num[r]; } } \
        LDS_BAR(); } while (0)
    for (int n = 0; n < T / 64; n += 2) {
        ml_load(F1, p, (n + 1) * 4 + h, offA, offV);
        ML_STEP(F0, n);
        ml_load(F0, p, ((n + 2 < T / 64) ? n + 2 : n) * 4 + h, offA, offV);
        ML_STEP(F1, n + 1);
    }
#undef ML_STEP
}


constexpr int QP = 132;
__device__ __forceinline__ void gdn_pre_item(const Params& p, int l, LAS unsigned char* lds, int item, int tid, int wave, int lane) {
    const int h = item & 3, n = item >> 2; const size_t t0 = (size_t)n * 64;
    const bf16* Z = (const bf16*)(p.ws + WS_Z); const float* SMALL = (const float*)(p.ws + WS_SMALL);
    float* GU = (float*)(p.ws + WS_GU) + (size_t)item * 8192; bf16* GNW = (bf16*)(p.ws + WS_GNW) + (size_t)item * 8192; bf16* GQG = (bf16*)(p.ws + WS_GQG) + (size_t)item * 8192;
    bf16* GAT = (bf16*)(p.ws + WS_GAT) + (size_t)item * 4096; bf16* GKT = (bf16*)(p.ws + WS_GKT) + (size_t)item * 8192; float* GDL = (float*)(p.ws + WS_GDL);
    const float* cw = p.in[I_CONVW] + (size_t)l * 4 * 1536;
    LAS float* qs = (LAS float*)lds; LAS float* ks = qs + 64 * QP; LAS float* vs = ks + 64 * QP; LAS float* Ls = vs + 64 * QP;   LAS float* gcs = Ls + 64 * 68; LAS float* bts = gcs + 64; LAS float* btg = bts + 64;
    { const int tk = tid >> 3, part = tid & 7;
#pragma unroll 1
      for (int i = 0; i < 3; ++i) { float a[16];
#pragma unroll
        for (int x = 0; x < 16; ++x) a[x] = 0.f;
#pragma unroll
        for (int j = 0; j < 4; ++j) { const long tt = (long)t0 + tk - 3 + j; if (tt >= 0) {
            const bf16* src = Z + (size_t)tt * ZC + ZC_GDN + i * 512 + h * 128 + 16 * part; float x0[8], x1[8]; unpack8(*(const v4u*)src, x0); unpack8(*(const v4u*)(src + 8), x1);
            const float* wp = cw + j * 1536 + i * 512 + h * 128 + 16 * part;
#pragma unroll
            for (int x = 0; x < 8; ++x) { a[x] += wp[x] * x0[x]; a[8 + x] += wp[8 + x] * x1[x]; } } }
        float ss = 0.f;
#pragma unroll
        for (int x = 0; x < 16; ++x) { a[x] = siluf_(a[x]); ss += a[x] * a[x]; }
        if (i < 2) { ss = sum8(ss); const float r = rsqrtf(ss + 1e-6f) * (i == 0 ? 0.08838834764831845f : 1.f);
#pragma unroll
            for (int x = 0; x < 16; ++x) a[x] *= r; }
        LAS float* dst = (i == 0 ? qs : (i == 1 ? ks : vs)) + tk * QP + 16 * part;
#pragma unroll
        for (int x4 = 0; x4 < 4; ++x4) *(LAS v4f*)(dst + 4 * x4) = (v4f){a[4 * x4], a[4 * x4 + 1], a[4 * x4 + 2], a[4 * x4 + 3]}; } }
    if (wave == 0) { const float bb = SMALL[(t0 + lane) * 16 + h], aa = SMALL[(t0 + lane) * 16 + 4 + h];
        const float g = -__expf(p.in[I_ALOG][l * 4 + h]) * softplusf_(aa + p.in[I_DTB][l * 4 + h]);
        const float gc = wave_scan_incl(g), bt = sigmoidf_(bb); gcs[lane] = gc; bts[lane] = bt; btg[lane] = bt * __expf(gc); }
    __syncthreads();
    { const int i = tid >> 3, jb = tid & 7; const float gi = gcs[i], bi = bts[i]; float dk[8], dq[8];
#pragma unroll
      for (int x = 0; x < 8; ++x) { dk[x] = 0.f; dq[x] = 0.f; }
      if (8 * jb <= i) {
#pragma unroll 2
          for (int d4 = 0; d4 < 32; ++d4) { const v4f qi = *(const LAS v4f*)(qs + i * QP + 4 * d4), ki = *(const LAS v4f*)(ks + i * QP + 4 * d4);
#pragma unroll
              for (int x = 0; x < 8; ++x) { const v4f kj = *(const LAS v4f*)(ks + (8 * jb + x) * QP + 4 * d4);
                  dk[x] += ki.x * kj.x + ki.y * kj.y + ki.z * kj.z + ki.w * kj.w; dq[x] += qi.x * kj.x + qi.y * kj.y + qi.z * kj.z + qi.w * kj.w; } }
#pragma unroll
          for (int x = 0; x < 8; ++x) { const int j = 8 * jb + x; const float dc = __expf(gi - gcs[j]); dk[x] = (j < i) ? bi * dk[x] * dc : 0.f; dq[x] = (j <= i) ? dq[x] * dc : 0.f; } }
      *(LAS v4f*)(Ls + i * 68 + 8 * jb) = (v4f){dk[0], dk[1], dk[2], dk[3]}; *(LAS v4f*)(Ls + i * 68 + 8 * jb + 4) = (v4f){dk[4], dk[5], dk[6], dk[7]};
      v4u w; w.x = pk2(dq[0], dq[1]); w.y = pk2(dq[2], dq[3]); w.z = pk2(dq[4], dq[5]); w.w = pk2(dq[6], dq[7]); *(v4u*)(GAT + i * 64 + 8 * jb) = w; }
    __syncthreads();
    if (tid < 256) {
        const int c = tid; int vz; asm volatile("v_mov_b32 %0, 0" : "=v"(vz));
        const LAS float* rp = (c < 128) ? (vs + c) : (ks + (c - 128)); const LAS float* mp = ((c < 128) ? bts : btg) + vz;
#define GDN_RHS(i) (rp[(i) * QP] * mp[(i)])
#define GDN_L4(i, j4) (*(const LAS v4f*)(Ls + (i) * 68 + 4 * (j4) + vz))
        float x0 = GDN_RHS(0); __builtin_amdgcn_sched_barrier(0);
        float x1 = GDN_RHS(1); { const v4f l = GDN_L4(1, 0); x1 -= l.x * x0; } __builtin_amdgcn_sched_barrier(0);
        float x2 = GDN_RHS(2); { const v4f l = GDN_L4(2, 0); x2 -= l.x * x0; x2 -= l.y * x1; } __builtin_amdgcn_sched_barrier(0);
        float x3 = GDN_RHS(3); { const v4f l = GDN_L4(3, 0); x3 -= l.x * x0; x3 -= l.y * x1; x3 -= l.z * x2; } __builtin_amdgcn_sched_barrier(0);
        float x4 = GDN_RHS(4); { const v4f l = GDN_L4(4, 0); x4 -= l.x * x0; x4 -= l.y * x1; x4 -= l.z * x2; x4 -= l.w * x3; } __builtin_amdgcn_sched_barrier(0);
        float x5 = GDN_RHS(5); { const v4f l = GDN_L4(5, 0); x5 -= l.x * x0; x5 -= l.y * x1; x5 -= l.z * x2; x5 -= l.w * x3; } { const v4f l = GDN_L4(5, 1); x5 -= l.x * x4; } __builtin_amdgcn_sched_barrier(0);
        float x6 = GDN_RHS(6); { const v4f l = GDN_L4(6, 0); x6 -= l.x * x0; x6 -= l.y * x1; x6 -= l.z * x2; x6 -= l.w * x3; } { const v4f l = GDN_L4(6, 1); x6 -= l.x * x4; x6 -= l.y * x5; } __builtin_amdgcn_sched_barrier(0);
        float x7 = GDN_RHS(7); { const v4f l = GDN_L4(7, 0); x7 -= l.x * x0; x7 -= l.y * x1; x7 -= l.z * x2; x7 -= l.w * x3; } { const v4f l = GDN_L4(7, 1); x7 -= l.x * x4; x7 -= l.y * x5; x7 -= l.z * x6; } __builtin_amdgcn_sched_barrier(0);
        float x8 = GDN_RHS(8); { const v4f l = GDN_L4(8, 0); x8 -= l.x * x0; x8 -= l.y * x1; x8 -= l.z * x2; x8 -= l.w * x3; } { const v4f l = GDN_L4(8, 1); x8 -= l.x * x4; x8 -= l.y * x5; x8 -= l.z * x6; x8 -= l.w * x7; } __builtin_amdgcn_sched_barrier(0);
        float x9 = GDN_RHS(9); { const v4f l = GDN_L4(9, 0); x9 -= l.x * x0; x9 -= l.y * x1; x9 -= l.z * x2; x9 -= l.w * x3; } { const v4f l = GDN_L4(9, 1); x9 -= l.x * x4; x9 -= l.y * x5; x9 -= l.z * x6; x9 -= l.w * x7; } { const v4f l = GDN_L4(9, 2); x9 -= l.x * x8; } __builtin_amdgcn_sched_barrier(0);
        float x10 = GDN_RHS(10); { const v4f l = GDN_L4(10, 0); x10 -= l.x * x0; x10 -= l.y * x1; x10 -= l.z * x2; x10 -= l.w * x3; } { const v4f l = GDN_L4(10, 1); x10 -= l.x * x4; x10 -= l.y * x5; x10 -= l.z * x6; x10 -= l.w * x7; } { const v4f l = GDN_L4(10, 2); x10 -= l.x * x8; x10 -= l.y * x9; } __builtin_amdgcn_sched_barrier(0);
        float x11 = GDN_RHS(11); { const v4f l = GDN_L4(11, 0); x11 -= l.x * x0; x11 -= l.y * x1; x11 -= l.z * x2; x11 -= l.w * x3; } { const v4f l = GDN_L4(11, 1); x11 -= l.x * x4; x11 -= l.y * x5; x11 -= l.z * x6; x11 -= l.w * x7; } { const v4f l = GDN_L4(11, 2); x11 -= l.x * x8; x11 -= l.y * x9; x11 -= l.z * x10; } __builtin_amdgcn_sched_barrier(0);
        float x12 = GDN_RHS(12); { const v4f l = GDN_L4(12, 0); x12 -= l.x * x0; x12 -= l.y * x1; x12 -= l.z * x2; x12 -= l.w * x3; } { const v4f l = GDN_L4(12, 1); x12 -= l.x * x4; x12 -= l.y * x5; x12 -= l.z * x6; x12 -= l.w * x7; } { const v4f l = GDN_L4(12, 2); x12 -= l.x * x8; x12 -= l.y * x9; x12 -= l.z * x10; x12 -= l.w * x11; } __builtin_amdgcn_sched_barrier(0);
        float x13 = GDN_RHS(13); { const v4f l = GDN_L4(13, 0); x13 -= l.x * x0; x13 -= l.y * x1; x13 -= l.z * x2; x13 -= l.w * x3; } { const v4f l = GDN_L4(13, 1); x13 -= l.x * x4; x13 -= l.y * x5; x13 -= l.z * x6; x13 -= l.w * x7; } { const v4f l = GDN_L4(13, 2); x13 -= l.x * x8; x13 -= l.y * x9; x13 -= l.z * x10; x13 -= l.w * x11; } { const v4f l = GDN_L4(13, 3); x13 -= l.x * x12; } __builtin_amdgcn_sched_barrier(0);
        float x14 = GDN_RHS(14); { const v4f l = GDN_L4(14, 0); x14 -= l.x * x0; x14 -= l.y * x1; x14 -= l.z * x2; x14 -= l.w * x3; } { const v4f l = GDN_L4(14, 1); x14 -= l.x * x4; x14 -= l.y * x5; x14 -= l.z * x6; x14 -= l.w * x7; } { const v4f l = GDN_L4(14, 2); x14 -= l.x * x8; x14 -= l.y * x9; x14 -= l.z * x10; x14 -= l.w * x11; } { const v4f l = GDN_L4(14, 3); x14 -= l.x * x12; x14 -= l.y * x13; } __builtin_amdgcn_sched_barrier(0);
        float x15 = GDN_RHS(15); { const v4f l = GDN_L4(15, 0); x15 -= l.x * x0; x15 -= l.y * x1; x15 -= l.z * x2; x15 -= l.w * x3; } { const v4f l = GDN_L4(15, 1); x15 -= l.x * x4; x15 -= l.y * x5; x15 -= l.z * x6; x15 -= l.w * x7; } { const v4f l = GDN_L4(15, 2); x15 -= l.x * x8; x15 -= l.y * x9; x15 -= l.z * x10; x15 -= l.w * x11; } { const v4f l = GDN_L4(15, 3); x15 -= l.x * x12; x15 -= l.y * x13; x15 -= l.z * x14; } __builtin_amdgcn_sched_barrier(0);
        float x16 = GDN_RHS(16); { const v4f l = GDN_L4(16, 0); x16 -= l.x * x0; x16 -= l.y * x1; x16 -= l.z * x2; x16 -= l.w * x3; } { const v4f l = GDN_L4(16, 1); x16 -= l.x * x4; x16 -= l.y * x5; x16 -= l.z * x6; x16 -= l.w * x7; } { const v4f l = GDN_L4(16, 2); x16 -= l.x * x8; x16 -= l.y * x9; x16 -= l.z * x10; x16 -= l.w * x11; } { const v4f l = GDN_L4(16, 3); x16 -= l.x * x12; x16 -= l.y * x13; x16 -= l.z * x14; x16 -= l.w * x15; } __builtin_amdgcn_sched_barrier(0);
        float x17 = GDN_RHS(17); { const v4f l = GDN_L4(17, 0); x17 -= l.x * x0; x17 -= l.y * x1; x17 -= l.z * x2; x17 -= l.w * x3; } { const v4f l = GDN_L4(17, 1); x17 -= l.x * x4; x17 -= l.y * x5; x17 -= l.z * x6; x17 -= l.w * x7; } { const v4f l = GDN_L4(17, 2); x17 -= l.x * x8; x17 -= l.y * x9; x17 -= l.z * x10; x17 -= l.w * x11; } { const v4f l = GDN_L4(17, 3); x17 -= l.x * x12; x17 -= l.y * x13; x17 -= l.z * x14; x17 -= l.w * x15; } { const v4f l = GDN_L4(17, 4); x17 -= l.x * x16; } __builtin_amdgcn_sched_barrier(0);
        float x18 = GDN_RHS(18); { const v4f l = GDN_L4(18, 0); x18 -= l.x * x0; x18 -= l.y * x1; x18 -= l.z * x2; x18 -= l.w * x3; } { const v4f l = GDN_L4(18, 1); x18 -= l.x * x4; x18 -= l.y * x5; x18 -= l.z * x6; x18 -= l.w * x7; } { const v4f l = GDN_L4(18, 2); x18 -= l.x * x8; x18 -= l.y * x9; x18 -= l.z * x10; x18 -= l.w * x11; } { const v4f l = GDN_L4(18, 3); x18 -= l.x * x12; x18 -= l.y * x13; x18 -= l.z * x14; x18 -= l.w * x15; } { const v4f l = GDN_L4(18, 4); x18 -= l.x * x16; x18 -= l.y * x17; } __builtin_amdgcn_sched_barrier(0);
        float x19 = GDN_RHS(19); { const v4f l = GDN_L4(19, 0); x19 -= l.x * x0; x19 -= l.y * x1; x19 -= l.z * x2; x19 -= l.w * x3; } { const v4f l = GDN_L4(19, 1); x19 -= l.x * x4; x19 -= l.y * x5; x19 -= l.z * x6; x19 -= l.w * x7; } { const v4f l = GDN_L4(19, 2); x19 -= l.x * x8; x19 -= l.y * x9; x19 -= l.z * x10; x19 -= l.w * x11; } { const v4f l = GDN_L4(19, 3); x19 -= l.x * x12; x19 -= l.y * x13; x19 -= l.z * x14; x19 -= l.w * x15; } { const v4f l = GDN_L4(19, 4); x19 -= l.x * x16; x19 -= l.y * x17; x19 -= l.z * x18; } __builtin_amdgcn_sched_barrier(0);
        float x20 = GDN_RHS(20); { const v4f l = GDN_L4(20, 0); x20 -= l.x * x0; x20 -= l.y * x1; x20 -= l.z * x2; x20 -= l.w * x3; } { const v4f l = GDN_L4(20, 1); x20 -= l.x * x4; x20 -= l.y * x5; x20 -= l.z * x6; x20 -= l.w * x7; } { const v4f l = GDN_L4(20, 2); x20 -= l.x * x8; x20 -= l.y * x9; x20 -= l.z * x10; x20 -= l.w * x11; } { const v4f l = GDN_L4(20, 3); x20 -= l.x * x12; x20 -= l.y * x13; x20 -= l.z * x14; x20 -= l.w * x15; } { const v4f l = GDN_L4(20, 4); x20 -= l.x * x16; x20 -= l.y * x17; x20 -= l.z * x18; x20 -= l.w * x19; } __builtin_amdgcn_sched_barrier(0);
        float x21 = GDN_RHS(21); { const v4f l = GDN_L4(21, 0); x21 -= l.x * x0; x21 -= l.y * x1; x21 -= l.z * x2; x21 -= l.w * x3; } { const v4f l = GDN_L4(21, 1); x21 -= l.x * x4; x21 -= l.y * x5; x21 -= l.z * x6; x21 -= l.w * x7; } { const v4f l = GDN_L4(21, 2); x21 -= l.x * x8; x21 -= l.y * x9; x21 -= l.z * x10; x21 -= l.w * x11; } { const v4f l = GDN_L4(21, 3); x21 -= l.x * x12; x21 -= l.y * x13; x21 -= l.z * x14; x21 -= l.w * x15; } { const v4f l = GDN_L4(21, 4); x21 -= l.x * x16; x21 -= l.y * x17; x21 -= l.z * x18; x21 -= l.w * x19; } { const v4f l = GDN_L4(21, 5); x21 -= l.x * x20; } __builtin_amdgcn_sched_barrier(0);
        float x22 = GDN_RHS(22); { const v4f l = GDN_L4(22, 0); x22 -= l.x * x0; x22 -= l.y * x1; x22 -= l.z * x2; x22 -= l.w * x3; } { const v4f l = GDN_L4(22, 1); x22 -= l.x * x4; x22 -= l.y * x5; x22 -= l.z * x6; x22 -= l.w * x7; } { const v4f l = GDN_L4(22, 2); x22 -= l.x * x8; x22 -= l.y * x9; x22 -= l.z * x10; x22 -= l.w * x11; } { const v4f l = GDN_L4(22, 3); x22 -= l.x * x12; x22 -= l.y * x13; x22 -= l.z * x14; x22 -= l.w * x15; } { const v4f l = GDN_L4(22, 4); x22 -= l.x * x16; x22 -= l.y * x17; x22 -= l.z * x18; x22 -= l.w * x19; } { const v4f l = GDN_L4(22, 5); x22 -= l.x * x20; x22 -= l.y * x21; } __builtin_amdgcn_sched_barrier(0);
        float x23 = GDN_RHS(23); { const v4f l = GDN_L4(23, 0); x23 -= l.x * x0; x23 -= l.y * x1; x23 -= l.z * x2; x23 -= l.w * x3; } { const v4f l = GDN_L4(23, 1); x23 -= l.x * x4; x23 -= l.y * x5; x23 -= l.z * x6; x23 -= l.w * x7; } { const v4f l = GDN_L4(23, 2); x23 -= l.x * x8; x23 -= l.y * x9; x23 -= l.z * x10; x23 -= l.w * x11; } { const v4f l = GDN_L4(23, 3); x23 -= l.x * x12; x23 -= l.y * x13; x23 -= l.z * x14; x23 -= l.w * x15; } { const v4f l = GDN_L4(23, 4); x23 -= l.x * x16; x23 -= l.y * x17; x23 -= l.z * x18; x23 -= l.w * x19; } { const v4f l = GDN_L4(23, 5); x23 -= l.x * x20; x23 -= l.y * x21; x23 -= l.z * x22; } __builtin_amdgcn_sched_barrier(0);
        float x24 = GDN_RHS(24); { const v4f l = GDN_L4(24, 0); x24 -= l.x * x0; x24 -= l.y * x1; x24 -= l.z * x2; x24 -= l.w * x3; } { const v4f l = GDN_L4(24, 1); x24 -= l.x * x4; x24 -= l.y * x5; x24 -= l.z * x6; x24 -= l.w * x7; } { const v4f l = GDN_L4(24, 2); x24 -= l.x * x8; x24 -= l.y * x9; x24 -= l.z * x10; x24 -= l.w * x11; } { const v4f l = GDN_L4(24, 3); x24 -= l.x * x12; x24 -= l.y * x13; x24 -= l.z * x14; x24 -= l.w * x15; } { const v4f l = GDN_L4(24, 4); x24 -= l.x * x16; x24 -= l.y * x17; x24 -= l.z * x18; x24 -= l.w * x19; } { const v4f l = GDN_L4(24, 5); x24 -= l.x * x20; x24 -= l.y * x21; x24 -= l.z * x22; x24 -= l.w * x23; } __builtin_amdgcn_sched_barrier(0);
        float x25 = GDN_RHS(25); { const v4f l = GDN_L4(25, 0); x25 -= l.x * x0; x25 -= l.y * x1; x25 -= l.z * x2; x25 -= l.w * x3; } { const v4f l = GDN_L4(25, 1); x25 -= l.x * x4; x25 -= l.y * x5; x25 -= l.z * x6; x25 -= l.w * x7; } { const v4f l = GDN_L4(25, 2); x25 -= l.x * x8; x25 -= l.y * x9; x25 -= l.z * x10; x25 -= l.w * x11; } { const v4f l = GDN_L4(25, 3); x25 -= l.x * x12; x25 -= l.y * x13; x25 -= l.z * x14; x25 -= l.w * x15; } { const v4f l = GDN_L4(25, 4); x25 -= l.x * x16; x25 -= l.y * x17; x25 -= l.z * x18; x25 -= l.w * x19; } { const v4f l = GDN_L4(25, 5); x25 -= l.x * x20; x25 -= l.y * x21; x25 -= l.z * x22; x25 -= l.w * x23; } { const v4f l = GDN_L4(25, 6); x25 -= l.x * x24; } __builtin_amdgcn_sched_barrier(0);
        float x26 = GDN_RHS(26); { const v4f l = GDN_L4(26, 0); x26 -= l.x * x0; x26 -= l.y * x1; x26 -= l.z * x2; x26 -= l.w * x3; } { const v4f l = GDN_L4(26, 1); x26 -= l.x * x4; x26 -= l.y * x5; x26 -= l.z * x6; x26 -= l.w * x7; } { const v4f l = GDN_L4(26, 2); x26 -= l.x * x8; x26 -= l.y * x9; x26 -= l.z * x10; x26 -= l.w * x11; } { const v4f l = GDN_L4(26, 3); x26 -= l.x * x12; x26 -= l.y * x13; x26 -= l.z * x14; x26 -= l.w * x15; } { const v4f l = GDN_L4(26, 4); x26 -= l.x * x16; x26 -= l.y * x17; x26 -= l.z * x18; x26 -= l.w * x19; } { const v4f l = GDN_L4(26, 5); x26 -= l.x * x20; x26 -= l.y * x21; x26 -= l.z * x22; x26 -= l.w * x23; } { const v4f l = GDN_L4(26, 6); x26 -= l.x * x24; x26 -= l.y * x25; } __builtin_amdgcn_sched_barrier(0);
        float x27 = GDN_RHS(27); { const v4f l = GDN_L4(27, 0); x27 -= l.x * x0; x27 -= l.y * x1; x27 -= l.z * x2; x27 -= l.w * x3; } { const v4f l = GDN_L4(27, 1); x27 -= l.x * x4; x27 -= l.y * x5; x27 -= l.z * x6; x27 -= l.w * x7; } { const v4f l = GDN_L4(27, 2); x27 -= l.x * x8; x27 -= l.y * x9; x27 -= l.z * x10; x27 -= l.w * x11; } { const v4f l = GDN_L4(27, 3); x27 -= l.x * x12; x27 -= l.y * x13; x27 -= l.z * x14; x27 -= l.w * x15; } { const v4f l = GDN_L4(27, 4); x27 -= l.x * x16; x27 -= l.y * x17; x27 -= l.z * x18; x27 -= l.w * x19; } { const v4f l = GDN_L4(27, 5); x27 -= l.x * x20; x27 -= l.y * x21; x27 -= l.z * x22; x27 -= l.w * x23; } { const v4f l = GDN_L4(27, 6); x27 -= l.x * x24; x27 -= l.y * x25; x27 -= l.z * x26; } __builtin_amdgcn_sched_barrier(0);
        float x28 = GDN_RHS(28); { const v4f l = GDN_L4(28, 0); x28 -= l.x * x0; x28 -= l.y * x1; x28 -= l.z * x2; x28 -= l.w * x3; } { const v4f l = GDN_L4(28, 1); x28 -= l.x * x4; x28 -= l.y * x5; x28 -= l.z * x6; x28 -= l.w * x7; } { const v4f l = GDN_L4(28, 2); x28 -= l.x * x8; x28 -= l.y * x9; x28 -= l.z * x10; x28 -= l.w * x11; } { const v4f l = GDN_L4(28, 3); x28 -= l.x * x12; x28 -= l.y * x13; x28 -= l.z * x14; x28 -= l.w * x15; } { const v4f l = GDN_L4(28, 4); x28 -= l.x * x16; x28 -= l.y * x17; x28 -= l.z * x18; x28 -= l.w * x19; } { const v4f l = GDN_L4(28, 5); x28 -= l.x * x20; x28 -= l.y * x21; x28 -= l.z * x22; x28 -= l.w * x23; } { const v4f l = GDN_L4(28, 6); x28 -= l.x * x24; x28 -= l.y * x25; x28 -= l.z * x26; x28 -= l.w * x27; } __builtin_amdgcn_sched_barrier(0);
        float x29 = GDN_RHS(29); { const v4f l = GDN_L4(29, 0); x29 -= l.x * x0; x29 -= l.y * x1; x29 -= l.z * x2; x29 -= l.w * x3; } { const v4f l = GDN_L4(29, 1); x29 -= l.x * x4; x29 -= l.y * x5; x29 -= l.z * x6; x29 -= l.w * x7; } { const v4f l = GDN_L4(29, 2); x29 -= l.x * x8; x29 -= l.y * x9; x29 -= l.z * x10; x29 -= l.w * x11; } { const v4f l = GDN_L4(29, 3); x29 -= l.x * x12; x29 -= l.y * x13; x29 -= l.z * x14; x29 -= l.w * x15; } { const v4f l = GDN_L4(29, 4); x29 -= l.x * x16; x29 -= l.y * x17; x29 -= l.z * x18; x29 -= l.w * x19; } { const v4f l = GDN_L4(29, 5); x29 -= l.x * x20; x29 -= l.y * x21; x29 -= l.z * x22; x29 -= l.w * x23; } { const v4f l = GDN_L4(29, 6); x29 -= l.x * x24; x29 -= l.y * x25; x29 -= l.z * x26; x29 -= l.w * x27; } { const v4f l = GDN_L4(29, 7); x29 -= l.x * x28; } __builtin_amdgcn_sched_barrier(0);
        float x30 = GDN_RHS(30); { const v4f l = GDN_L4(30, 0); x30 -= l.x * x0; x30 -= l.y * x1; x30 -= l.z * x2; x30 -= l.w * x3; } { const v4f l = GDN_L4(30, 1); x30 -= l.x * x4; x30 -= l.y * x5; x30 -= l.z * x6; x30 -= l.w * x7; } { const v4f l = GDN_L4(30, 2); x30 -= l.x * x8; x30 -= l.y * x9; x30 -= l.z * x10; x30 -= l.w * x11; } { const v4f l = GDN_L4(30, 3); x30 -= l.x * x12; x30 -= l.y * x13; x30 -= l.z * x14; x30 -= l.w * x15; } { const v4f l = GDN_L4(30, 4); x30 -= l.x * x16; x30 -= l.y * x17; x30 -= l.z * x18; x30 -= l.w * x19; } { const v4f l = GDN_L4(30, 5); x30 -= l.x * x20; x30 -= l.y * x21; x30 -= l.z * x22; x30 -= l.w * x23; } { const v4f l = GDN_L4(30, 6); x30 -= l.x * x24; x30 -= l.y * x25; x30 -= l.z * x26; x30 -= l.w * x27; } { const v4f l = GDN_L4(30, 7); x30 -= l.x * x28; x30 -= l.y * x29; } __builtin_amdgcn_sched_barrier(0);
        float x31 = GDN_RHS(31); { const v4f l = GDN_L4(31, 0); x31 -= l.x * x0; x31 -= l.y * x1; x31 -= l.z * x2; x31 -= l.w * x3; } { const v4f l = GDN_L4(31, 1); x31 -= l.x * x4; x31 -= l.y * x5; x31 -= l.z * x6; x31 -= l.w * x7; } { const v4f l = GDN_L4(31, 2); x31 -= l.x * x8; x31 -= l.y * x9; x31 -= l.z * x10; x31 -= l.w * x11; } { const v4f l = GDN_L4(31, 3); x31 -= l.x * x12; x31 -= l.y * x13; x31 -= l.z * x14; x31 -= l.w * x15; } { const v4f l = GDN_L4(31, 4); x31 -= l.x * x16; x31 -= l.y * x17; x31 -= l.z * x18; x31 -= l.w * x19; } { const v4f l = GDN_L4(31, 5); x31 -= l.x * x20; x31 -= l.y * x21; x31 -= l.z * x22; x31 -= l.w * x23; } { const v4f l = GDN_L4(31, 6); x31 -= l.x * x24; x31 -= l.y * x25; x31 -= l.z * x26; x31 -= l.w * x27; } { const v4f l = GDN_L4(31, 7); x31 -= l.x * x28; x31 -= l.y * x29; x31 -= l.z * x30; } __builtin_amdgcn_sched_barrier(0);
        float x32 = GDN_RHS(32); { const v4f l = GDN_L4(32, 0); x32 -= l.x * x0; x32 -= l.y * x1; x32 -= l.z * x2; x32 -= l.w * x3; } { const v4f l = GDN_L4(32, 1); x32 -= l.x * x4; x32 -= l.y * x5; x32 -= l.z * x6; x32 -= l.w * x7; } { const v4f l = GDN_L4(32, 2); x32 -= l.x * x8; x32 -= l.y * x9; x32 -= l.z * x10; x32 -= l.w * x11; } { const v4f l = GDN_L4(32, 3); x32 -= l.x * x12; x32 -= l.y * x13; x32 -= l.z * x14; x32 -= l.w * x15; } { const v4f l = GDN_L4(32, 4); x32 -= l.x * x16; x32 -= l.y * x17; x32 -= l.z * x18; x32 -= l.w * x19; } { const v4f l = GDN_L4(32, 5); x32 -= l.x * x20; x32 -= l.y * x21; x32 -= l.z * x22; x32 -= l.w * x23; } { const v4f l = GDN_L4(32, 6); x32 -= l.x * x24; x32 -= l.y * x25; x32 -= l.z * x26; x32 -= l.w * x27; } { const v4f l = GDN_L4(32, 7); x32 -= l.x * x28; x32 -= l.y * x29; x32 -= l.z * x30; x32 -= l.w * x31; } __builtin_amdgcn_sched_barrier(0);
        float x33 = GDN_RHS(33); { const v4f l = GDN_L4(33, 0); x33 -= l.x * x0; x33 -= l.y * x1; x33 -= l.z * x2; x33 -= l.w * x3; } { const v4f l = GDN_L4(33, 1); x33 -= l.x * x4; x33 -= l.y * x5; x33 -= l.z * x6; x33 -= l.w * x7; } { const v4f l = GDN_L4(33, 2); x33 -= l.x * x8; x33 -= l.y * x9; x33 -= l.z * x10; x33 -= l.w * x11; } { const v4f l = GDN_L4(33, 3); x33 -= l.x * x12; x33 -= l.y * x13; x33 -= l.z * x14; x33 -= l.w * x15; } { const v4f l = GDN_L4(33, 4); x33 -= l.x * x16; x33 -= l.y * x17; x33 -= l.z * x18; x33 -= l.w * x19; } { const v4f l = GDN_L4(33, 5); x33 -= l.x * x20; x33 -= l.y * x21; x33 -= l.z * x22; x33 -= l.w * x23; } { const v4f l = GDN_L4(33, 6); x33 -= l.x * x24; x33 -= l.y * x25; x33 -= l.z * x26; x33 -= l.w * x27; } { const v4f l = GDN_L4(33, 7); x33 -= l.x * x28; x33 -= l.y * x29; x33 -= l.z * x30; x33 -= l.w * x31; } { const v4f l = GDN_L4(33, 8); x33 -= l.x * x32; } __builtin_amdgcn_sched_barrier(0);
        float x34 = GDN_RHS(34); { const v4f l = GDN_L4(34, 0); x34 -= l.x * x0; x34 -= l.y * x1; x34 -= l.z * x2; x34 -= l.w * x3; } { const v4f l = GDN_L4(34, 1); x34 -= l.x * x4; x34 -= l.y * x5; x34 -= l.z * x6; x34 -= l.w * x7; } { const v4f l = GDN_L4(34, 2); x34 -= l.x * x8; x34 -= l.y * x9; x34 -= l.z * x10; x34 -= l.w * x11; } { const v4f l = GDN_L4(34, 3); x34 -= l.x * x12; x34 -= l.y * x13; x34 -= l.z * x14; x34 -= l.w * x15; } { const v4f l = GDN_L4(34, 4); x34 -= l.x * x16; x34 -= l.y * x17; x34 -= l.z * x18; x34 -= l.w * x19; } { const v4f l = GDN_L4(34, 5); x34 -= l.x * x20; x34 -= l.y * x21; x34 -= l.z * x22; x34 -= l.w * x23; } { const v4f l = GDN_L4(34, 6); x34 -= l.x * x24; x34 -= l.y * x25; x34 -= l.z * x26; x34 -= l.w * x27; } { const v4f l = GDN_L4(34, 7); x34 -= l.x * x28; x34 -= l.y * x29; x34 -= l.z * x30; x34 -= l.w * x31; } { const v4f l = GDN_L4(34, 8); x34 -= l.x * x32; x34 -= l.y * x33; } __builtin_amdgcn_sched_barrier(0);
        float x35 = GDN_RHS(35); { const v4f l = GDN_L4(35, 0); x35 -= l.x * x0; x35 -= l.y * x1; x35 -= l.z * x2; x35 -= l.w * x3; } { const v4f l = GDN_L4(35, 1); x35 -= l.x * x4; x35 -= l.y * x5; x35 -= l.z * x6; x35 -= l.w * x7; } { const v4f l = GDN_L4(35, 2); x35 -= l.x * x8; x35 -= l.y * x9; x35 -= l.z * x10; x35 -= l.w * x11; } { const v4f l = GDN_L4(35, 3); x35 -= l.x * x12; x35 -= l.y * x13; x35 -= l.z * x14; x35 -= l.w * x15; } { const v4f l = GDN_L4(35, 4); x35 -= l.x * x16; x35 -= l.y * x17; x35 -= l.z * x18; x35 -= l.w * x19; } { const v4f l = GDN_L4(35, 5); x35 -= l.x * x20; x35 -= l.y * x21; x35 -= l.z * x22; x35 -= l.w * x23; } { const v4f l = GDN_L4(35, 6); x35 -= l.x * x24; x35 -= l.y * x25; x35 -= l.z * x26; x35 -= l.w * x27; } { const v4f l = GDN_L4(35, 7); x35 -= l.x * x28; x35 -= l.y * x29; x35 -= l.z * x30; x35 -= l.w * x31; } { const v4f l = GDN_L4(35, 8); x35 -= l.x * x32; x35 -= l.y * x33; x35 -= l.z * x34; } __builtin_amdgcn_sched_barrier(0);
        float x36 = GDN_RHS(36); { const v4f l = GDN_L4(36, 0); x36 -= l.x * x0; x36 -= l.y * x1; x36 -= l.z * x2; x36 -= l.w * x3; } { const v4f l = GDN_L4(36, 1); x36 -= l.x * x4; x36 -= l.y * x5; x36 -= l.z * x6; x36 -= l.w * x7; } { const v4f l = GDN_L4(36, 2); x36 -= l.x * x8; x36 -= l.y * x9; x36 -= l.z * x10; x36 -= l.w * x11; } { const v4f l = GDN_L4(36, 3); x36 -= l.x * x12; x36 -= l.y * x13; x36 -= l.z * x14; x36 -= l.w * x15; } { const v4f l = GDN_L4(36, 4); x36 -= l.x * x16; x36 -= l.y * x17; x36 -= l.z * x18; x36 -= l.w * x19; } { const v4f l = GDN_L4(36, 5); x36 -= l.x * x20; x36 -= l.y * x21; x36 -= l.z * x22; x36 -= l.w * x23; } { const v4f l = GDN_L4(36, 6); x36 -= l.x * x24; x36 -= l.y * x25; x36 -= l.z * x26; x36 -= l.w * x27; } { const v4f l = GDN_L4(36, 7); x36 -= l.x * x28; x36 -= l.y * x29; x36 -= l.z * x30; x36 -= l.w * x31; } { const v4f l = GDN_L4(36, 8); x36 -= l.x * x32; x36 -= l.y * x33; x36 -= l.z * x34; x36 -= l.w * x35; } __builtin_amdgcn_sched_barrier(0);
        float x37 = GDN_RHS(37); { const v4f l = GDN_L4(37, 0); x37 -= l.x * x0; x37 -= l.y * x1; x37 -= l.z * x2; x37 -= l.w * x3; } { const v4f l = GDN_L4(37, 1); x37 -= l.x * x4; x37 -= l.y * x5; x37 -= l.z * x6; x37 -= l.w * x7; } { const v4f l = GDN_L4(37, 2); x37 -= l.x * x8; x37 -= l.y * x9; x37 -= l.z * x10; x37 -= l.w * x11; } { const v4f l = GDN_L4(37, 3); x37 -= l.x * x12; x37 -= l.y * x13; x37 -= l.z * x14; x37 -= l.w * x15; } { const v4f l = GDN_L4(37, 4); x37 -= l.x * x16; x37 -= l.y * x17; x37 -= l.z * x18; x37 -= l.w * x19; } { const v4f l = GDN_L4(37, 5); x37 -= l.x * x20; x37 -= l.y * x21; x37 -= l.z * x22; x37 -= l.w * x23; } { const v4f l = GDN_L4(37, 6); x37 -= l.x * x24; x37 -= l.y * x25; x37 -= l.z * x26; x37 -= l.w * x27; } { const v4f l = GDN_L4(37, 7); x37 -= l.x * x28; x37 -= l.y * x29; x37 -= l.z * x30; x37 -= l.w * x31; } { const v4f l = GDN_L4(37, 8); x37 -= l.x * x32; x37 -= l.y * x33; x37 -= l.z * x34; x37 -= l.w * x35; } { const v4f l = GDN_L4(37, 9); x37 -= l.x * x36; } __builtin_amdgcn_sched_barrier(0);
        float x38 = GDN_RHS(38); { const v4f l = GDN_L4(38, 0); x38 -= l.x * x0; x38 -= l.y * x1; x38 -= l.z * x2; x38 -= l.w * x3; } { const v4f l = GDN_L4(38, 1); x38 -= l.x * x4; x38 -= l.y * x5; x38 -= l.z * x6; x38 -= l.w * x7; } { const v4f l = GDN_L4(38, 2); x38 -= l.x * x8; x38 -= l.y * x9; x38 -= l.z * x10; x38 -= l.w * x11; } { const v4f l = GDN_L4(38, 3); x38 -= l.x * x12; x38 -= l.y * x13; x38 -= l.z * x14; x38 -= l.w * x15; } { const v4f l = GDN_L4(38, 4); x38 -= l.x * x16; x38 -= l.y * x17; x38 -= l.z * x18; x38 -= l.w * x19; } { const v4f l = GDN_L4(38, 5); x38 -= l.x * x20; x38 -= l.y * x21; x38 -= l.z * x22; x38 -= l.w * x23; } { const v4f l = GDN_L4(38, 6); x38 -= l.x * x24; x38 -= l.y * x25; x38 -= l.z * x26; x38 -= l.w * x27; } { const v4f l = GDN_L4(38, 7); x38 -= l.x * x28; x38 -= l.y * x29; x38 -= l.z * x30; x38 -= l.w * x31; } { const v4f l = GDN_L4(38, 8); x38 -= l.x * x32; x38 -= l.y * x33; x38 -= l.z * x34; x38 -= l.w * x35; } { const v4f l = GDN_L4(38, 9); x38 -= l.x * x36; x38 -= l.y * x37; } __builtin_amdgcn_sched_barrier(0);
        float x39 = GDN_RHS(39); { const v4f l = GDN_L4(39, 0); x39 -= l.x * x0; x39 -= l.y * x1; x39 -= l.z * x2; x39 -= l.w * x3; } { const v4f l = GDN_L4(39, 1); x39 -= l.x * x4; x39 -= l.y * x5; x39 -= l.z * x6; x39 -= l.w * x7; } { const v4f l = GDN_L4(39, 2); x39 -= l.x * x8; x39 -= l.y * x9; x39 -= l.z * x10; x39 -= l.w * x11; } { const v4f l = GDN_L4(39, 3); x39 -= l.x * x12; x39 -= l.y * x13; x39 -= l.z * x14; x39 -= l.w * x15; } { const v4f l = GDN_L4(39, 4); x39 -= l.x * x16; x39 -= l.y * x17; x39 -= l.z * x18; x39 -= l.w * x19; } { const v4f l = GDN_L4(39, 5); x39 -= l.x * x20; x39 -= l.y * x21; x39 -= l.z * x22; x39 -= l.w * x23; } { const v4f l = GDN_L4(39, 6); x39 -= l.x * x24; x39 -= l.y * x25; x39 -= l.z * x26; x39 -= l.w * x27; } { const v4f l = GDN_L4(39, 7); x39 -= l.x * x28; x39 -= l.y * x29; x39 -= l.z * x30; x39 -= l.w * x31; } { const v4f l = GDN_L4(39, 8); x39 -= l.x * x32; x39 -= l.y * x33; x39 -= l.z * x34; x39 -= l.w * x35; } { const v4f l = GDN_L4(39, 9); x39 -= l.x * x36; x39 -= l.y * x37; x39 -= l.z * x38; } __builtin_amdgcn_sched_barrier(0);
        float x40 = GDN_RHS(40); { const v4f l = GDN_L4(40, 0); x40 -= l.x * x0; x40 -= l.y * x1; x40 -= l.z * x2; x40 -= l.w * x3; } { const v4f l = GDN_L4(40, 1); x40 -= l.x * x4; x40 -= l.y * x5; x40 -= l.z * x6; x40 -= l.w * x7; } { const v4f l = GDN_L4(40, 2); x40 -= l.x * x8; x40 -= l.y * x9; x40 -= l.z * x10; x40 -= l.w * x11; } { const v4f l = GDN_L4(40, 3); x40 -= l.x * x12; x40 -= l.y * x13; x40 -= l.z * x14; x40 -= l.w * x15; } { const v4f l = GDN_L4(40, 4); x40 -= l.x * x16; x40 -= l.y * x17; x40 -= l.z * x18; x40 -= l.w * x19; } { const v4f l = GDN_L4(40, 5); x40 -= l.x * x20; x40 -= l.y * x21; x40 -= l.z * x22; x40 -= l.w * x23; } { const v4f l = GDN_L4(40, 6); x40 -= l.x * x24; x40 -= l.y * x25; x40 -= l.z * x26; x40 -= l.w * x27; } { const v4f l = GDN_L4(40, 7); x40 -= l.x * x28; x40 -= l.y * x29; x40 -= l.z * x30; x40 -= l.w * x31; } { const v4f l = GDN_L4(40, 8); x40 -= l.x * x32; x40 -= l.y * x33; x40 -= l.z * x34; x40 -= l.w * x35; } { const v4f l = GDN_L4(40, 9); x40 -= l.x * x36; x40 -= l.y * x37; x40 -= l.z * x38; x40 -= l.w * x39; } __builtin_amdgcn_sched_barrier(0);
        float x41 = GDN_RHS(41); { const v4f l = GDN_L4(41, 0); x41 -= l.x * x0; x41 -= l.y * x1; x41 -= l.z * x2; x41 -= l.w * x3; } { const v4f l = GDN_L4(41, 1); x41 -= l.x * x4; x41 -= l.y * x5; x41 -= l.z * x6; x41 -= l.w * x7; } { const v4f l = GDN_L4(41, 2); x41 -= l.x * x8; x41 -= l.y * x9; x41 -= l.z * x10; x41 -= l.w * x11; } { const v4f l = GDN_L4(41, 3); x41 -= l.x * x12; x41 -= l.y * x13; x41 -= l.z * x14; x41 -= l.w * x15; } { const v4f l = GDN_L4(41, 4); x41 -= l.x * x16; x41 -= l.y * x17; x41 -= l.z * x18; x41 -= l.w * x19; } { const v4f l = GDN_L4(41, 5); x41 -= l.x * x20; x41 -= l.y * x21; x41 -= l.z * x22; x41 -= l.w * x23; } { const v4f l = GDN_L4(41, 6); x41 -= l.x * x24; x41 -= l.y * x25; x41 -= l.z * x26; x41 -= l.w * x27; } { const v4f l = GDN_L4(41, 7); x41 -= l.x * x28; x41 -= l.y * x29; x41 -= l.z * x30; x41 -= l.w * x31; } { const v4f l = GDN_L4(41, 8); x41 -= l.x * x32; x41 -= l.y * x33; x41 -= l.z * x34; x41 -= l.w * x35; } { const v4f l = GDN_L4(41, 9); x41 -= l.x * x36; x41 -= l.y * x37; x41 -= l.z * x38; x41 -= l.w * x39; } { const v4f l = GDN_L4(41, 10); x41 -= l.x * x40; } __builtin_amdgcn_sched_barrier(0);
        float x42 = GDN_RHS(42); { const v4f l = GDN_L4(42, 0); x42 -= l.x * x0; x42 -= l.y * x1; x42 -= l.z * x2; x42 -= l.w * x3; } { const v4f l = GDN_L4(42, 1); x42 -= l.x * x4; x42 -= l.y * x5; x42 -= l.z * x6; x42 -= l.w * x7; } { const v4f l = GDN_L4(42, 2); x42 -= l.x * x8; x42 -= l.y * x9; x42 -= l.z * x10; x42 -= l.w * x11; } { const v4f l = GDN_L4(42, 3); x42 -= l.x * x12; x42 -= l.y * x13; x42 -= l.z * x14; x42 -= l.w * x15; } { const v4f l = GDN_L4(42, 4); x42 -= l.x * x16; x42 -= l.y * x17; x42 -= l.z * x18; x42 -= l.w * x19; } { const v4f l = GDN_L4(42, 5); x42 -= l.x * x20; x42 -= l.y * x21; x42 -= l.z * x22; x42 -= l.w * x23; } { const v4f l = GDN_L4(42, 6); x42 -= l.x * x24; x42 -= l.y * x25; x42 -= l.z * x26; x42 -= l.w * x27; } { const v4f l = GDN_L4(42, 7); x42 -= l.x * x28; x42 -= l.y * x29; x42 -= l.z * x30; x42 -= l.w * x31; } { const v4f l = GDN_L4(42, 8); x42 -= l.x * x32; x42 -= l.y * x33; x42 -= l.z * x34; x42 -= l.w * x35; } { const v4f l = GDN_L4(42, 9); x42 -= l.x * x36; x42 -= l.y * x37; x42 -= l.z * x38; x42 -= l.w * x39; } { const v4f l = GDN_L4(42, 10); x42 -= l.x * x40; x42 -= l.y * x41; } __builtin_amdgcn_sched_barrier(0);
        float x43 = GDN_RHS(43); { const v4f l = GDN_L4(43, 0); x43 -= l.x * x0; x43 -= l.y * x1; x43 -= l.z * x2; x43 -= l.w * x3; } { const v4f l = GDN_L4(43, 1); x43 -= l.x * x4; x43 -= l.y * x5; x43 -= l.z * x6; x43 -= l.w * x7; } { const v4f l = GDN_L4(43, 2); x43 -= l.x * x8; x43 -= l.y * x9; x43 -= l.z * x10; x43 -= l.w * x11; } { const v4f l = GDN_L4(43, 3); x43 -= l.x * x12; x43 -= l.y * x13; x43 -= l.z * x14; x43 -= l.w * x15; } { const v4f l = GDN_L4(43, 4); x43 -= l.x * x16; x43 -= l.y * x17; x43 -= l.z * x18; x43 -= l.w * x19; } { const v4f l = GDN_L4(43, 5); x43 -= l.x * x20; x43 -= l.y * x21; x43 -= l.z * x22; x43 -= l.w * x23; } { const v4f l = GDN_L4(43, 6); x43 -= l.x * x24; x43 -= l.y * x25; x43 -= l.z * x26; x43 -= l.w * x27; } { const v4f l = GDN_L4(43, 7); x43 -= l.x * x28; x43 -= l.y * x29; x43 -= l.z * x30; x43 -= l.w * x31; } { const v4f l = GDN_L4(43, 8); x43 -= l.x * x32; x43 -= l.y * x33; x43 -= l.z * x34; x43 -= l.w * x35; } { const v4f l = GDN_L4(43, 9); x43 -= l.x * x36; x43 -= l.y * x37; x43 -= l.z * x38; x43 -= l.w * x39; } { const v4f l = GDN_L4(43, 10); x43 -= l.x * x40; x43 -= l.y * x41; x43 -= l.z * x42; } __builtin_amdgcn_sched_barrier(0);
        float x44 = GDN_RHS(44); { const v4f l = GDN_L4(44, 0); x44 -= l.x * x0; x44 -= l.y * x1; x44 -= l.z * x2; x44 -= l.w * x3; } { const v4f l = GDN_L4(44, 1); x44 -= l.x * x4; x44 -= l.y * x5; x44 -= l.z * x6; x44 -= l.w * x7; } { const v4f l = GDN_L4(44, 2); x44 -= l.x * x8; x44 -= l.y * x9; x44 -= l.z * x10; x44 -= l.w * x11; } { const v4f l = GDN_L4(44, 3); x44 -= l.x * x12; x44 -= l.y * x13; x44 -= l.z * x14; x44 -= l.w * x15; } { const v4f l = GDN_L4(44, 4); x44 -= l.x * x16; x44 -= l.y * x17; x44 -= l.z * x18; x44 -= l.w * x19; } { const v4f l = GDN_L4(44, 5); x44 -= l.x * x20; x44 -= l.y * x21; x44 -= l.z * x22; x44 -= l.w * x23; } { const v4f l = GDN_L4(44, 6); x44 -= l.x * x24; x44 -= l.y * x25; x44 -= l.z * x26; x44 -= l.w * x27; } { const v4f l = GDN_L4(44, 7); x44 -= l.x * x28; x44 -= l.y * x29; x44 -= l.z * x30; x44 -= l.w * x31; } { const v4f l = GDN_L4(44, 8); x44 -= l.x * x32; x44 -= l.y * x33; x44 -= l.z * x34; x44 -= l.w * x35; } { const v4f l = GDN_L4(44, 9); x44 -= l.x * x36; x44 -= l.y * x37; x44 -= l.z * x38; x44 -= l.w * x39; } { const v4f l = GDN_L4(44, 10); x44 -= l.x * x40; x44 -= l.y * x41; x44 -= l.z * x42; x44 -= l.w * x43; } __builtin_amdgcn_sched_barrier(0);
        float x45 = GDN_RHS(45); { const v4f l = GDN_L4(45, 0); x45 -= l.x * x0; x45 -= l.y * x1; x45 -= l.z * x2; x45 -= l.w * x3; } { const v4f l = GDN_L4(45, 1); x45 -= l.x * x4; x45 -= l.y * x5; x45 -= l.z * x6; x45 -= l.w * x7; } { const v4f l = GDN_L4(45, 2); x45 -= l.x * x8; x45 -= l.y * x9; x45 -= l.z * x10; x45 -= l.w * x11; } { const v4f l = GDN_L4(45, 3); x45 -= l.x * x12; x45 -= l.y * x13; x45 -= l.z * x14; x45 -= l.w * x15; } { const v4f l = GDN_L4(45, 4); x45 -= l.x * x16; x45 -= l.y * x17; x45 -= l.z * x18; x45 -= l.w * x19; } { const v4f l = GDN_L4(45, 5); x45 -= l.x * x20; x45 -= l.y * x21; x45 -= l.z * x22; x45 -= l.w * x23; } { const v4f l = GDN_L4(45, 6); x45 -= l.x * x24; x45 -= l.y * x25; x45 -= l.z * x26; x45 -= l.w * x27; } { const v4f l = GDN_L4(45, 7); x45 -= l.x * x28; x45 -= l.y * x29; x45 -= l.z * x30; x45 -= l.w * x31; } { const v4f l = GDN_L4(45, 8); x45 -= l.x * x32; x45 -= l.y * x33; x45 -= l.z * x34; x45 -= l.w * x35; } { const v4f l = GDN_L4(45, 9); x45 -= l.x * x36; x45 -= l.y * x37; x45 -= l.z * x38; x45 -= l.w * x39; } { const v4f l = GDN_L4(45, 10); x45 -= l.x * x40; x45 -= l.y * x41; x45 -= l.z * x42; x45 -= l.w * x43; } { const v4f l = GDN_L4(45, 11); x45 -= l.x * x44; } __builtin_amdgcn_sched_barrier(0);
        float x46 = GDN_RHS(46); { const v4f l = GDN_L4(46, 0); x46 -= l.x * x0; x46 -= l.y * x1; x46 -= l.z * x2; x46 -= l.w * x3; } { const v4f l = GDN_L4(46, 1); x46 -= l.x * x4; x46 -= l.y * x5; x46 -= l.z * x6; x46 -= l.w * x7; } { const v4f l = GDN_L4(46, 2); x46 -= l.x * x8; x46 -= l.y * x9; x46 -= l.z * x10; x46 -= l.w * x11; } { const v4f l = GDN_L4(46, 3); x46 -= l.x * x12; x46 -= l.y * x13; x46 -= l.z * x14; x46 -= l.w * x15; } { const v4f l = GDN_L4(46, 4); x46 -= l.x * x16; x46 -= l.y * x17; x46 -= l.z * x18; x46 -= l.w * x19; } { const v4f l = GDN_L4(46, 5); x46 -= l.x * x20; x46 -= l.y * x21; x46 -= l.z * x22; x46 -= l.w * x23; } { const v4f l = GDN_L4(46, 6); x46 -= l.x * x24; x46 -= l.y * x25; x46 -= l.z * x26; x46 -= l.w * x27; } { const v4f l = GDN_L4(46, 7); x46 -= l.x * x28; x46 -= l.y * x29; x46 -= l.z * x30; x46 -= l.w * x31; } { const v4f l = GDN_L4(46, 8); x46 -= l.x * x32; x46 -= l.y * x33; x46 -= l.z * x34; x46 -= l.w * x35; } { const v4f l = GDN_L4(46, 9); x46 -= l.x * x36; x46 -= l.y * x37; x46 -= l.z * x38; x46 -= l.w * x39; } { const v4f l = GDN_L4(46, 10); x46 -= l.x * x40; x46 -= l.y * x41; x46 -= l.z * x42; x46 -= l.w * x43; } { const v4f l = GDN_L4(46, 11); x46 -= l.x * x44; x46 -= l.y * x45; } __builtin_amdgcn_sched_barrier(0);
        float x47 = GDN_RHS(47); { const v4f l = GDN_L4(47, 0); x47 -= l.x * x0; x47 -= l.y * x1; x47 -= l.z * x2; x47 -= l.w * x3; } { const v4f l = GDN_L4(47, 1); x47 -= l.x * x4; x47 -= l.y * x5; x47 -= l.z * x6; x47 -= l.w * x7; } { const v4f l = GDN_L4(47, 2); x47 -= l.x * x8; x47 -= l.y * x9; x47 -= l.z * x10; x47 -= l.w * x11; } { const v4f l = GDN_L4(47, 3); x47 -= l.x * x12; x47 -= l.y * x13; x47 -= l.z * x14; x47 -= l.w * x15; } { const v4f l = GDN_L4(47, 4); x47 -= l.x * x16; x47 -= l.y * x17; x47 -= l.z * x18; x47 -= l.w * x19; } { const v4f l = GDN_L4(47, 5); x47 -= l.x * x20; x47 -= l.y * x21; x47 -= l.z * x22; x47 -= l.w * x23; } { const v4f l = GDN_L4(47, 6); x47 -= l.x * x24; x47 -= l.y * x25; x47 -= l.z * x26; x47 -= l.w * x27; } { const v4f l = GDN_L4(47, 7); x47 -= l.x * x28; x47 -= l.y * x29; x47 -= l.z * x30; x47 -= l.w * x31; } { const v4f l = GDN_L4(47, 8); x47 -= l.x * x32; x47 -= l.y * x33; x47 -= l.z * x34; x47 -= l.w * x35; } { const v4f l = GDN_L4(47, 9); x47 -= l.x * x36; x47 -= l.y * x37; x47 -= l.z * x38; x47 -= l.w * x39; } { const v4f l = GDN_L4(47, 10); x47 -= l.x * x40; x47 -= l.y * x41; x47 -= l.z * x42; x47 -= l.w * x43; } { const v4f l = GDN_L4(47, 11); x47 -= l.x * x44; x47 -= l.y * x45; x47 -= l.z * x46; } __builtin_amdgcn_sched_barrier(0);
        float x48 = GDN_RHS(48); { const v4f l = GDN_L4(48, 0); x48 -= l.x * x0; x48 -= l.y * x1; x48 -= l.z * x2; x48 -= l.w * x3; } { const v4f l = GDN_L4(48, 1); x48 -= l.x * x4; x48 -= l.y * x5; x48 -= l.z * x6; x48 -= l.w * x7; } { const v4f l = GDN_L4(48, 2); x48 -= l.x * x8; x48 -= l.y * x9; x48 -= l.z * x10; x48 -= l.w * x11; } { const v4f l = GDN_L4(48, 3); x48 -= l.x * x12; x48 -= l.y * x13; x48 -= l.z * x14; x48 -= l.w * x15; } { const v4f l = GDN_L4(48, 4); x48 -= l.x * x16; x48 -= l.y * x17; x48 -= l.z * x18; x48 -= l.w * x19; } { const v4f l = GDN_L4(48, 5); x48 -= l.x * x20; x48 -= l.y * x21; x48 -= l.z * x22; x48 -= l.w * x23; } { const v4f l = GDN_L4(48, 6); x48 -= l.x * x24; x48 -= l.y * x25; x48 -= l.z * x26; x48 -= l.w * x27; } { const v4f l = GDN_L4(48, 7); x48 -= l.x * x28; x48 -= l.y * x29; x48 -= l.z * x30; x48 -= l.w * x31; } { const v4f l = GDN_L4(48, 8); x48 -= l.x * x32; x48 -= l.y * x33; x48 -= l.z * x34; x48 -= l.w * x35; } { const v4f l = GDN_L4(48, 9); x48 -= l.x * x36; x48 -= l.y * x37; x48 -= l.z * x38; x48 -= l.w * x39; } { const v4f l = GDN_L4(48, 10); x48 -= l.x * x40; x48 -= l.y * x41; x48 -= l.z * x42; x48 -= l.w * x43; } { const v4f l = GDN_L4(48, 11); x48 -= l.x * x44; x48 -= l.y * x45; x48 -= l.z * x46; x48 -= l.w * x47; } __builtin_amdgcn_sched_barrier(0);
        float x49 = GDN_RHS(49); { const v4f l = GDN_L4(49, 0); x49 -= l.x * x0; x49 -= l.y * x1; x49 -= l.z * x2; x49 -= l.w * x3; } { const v4f l = GDN_L4(49, 1); x49 -= l.x * x4; x49 -= l.y * x5; x49 -= l.z * x6; x49 -= l.w * x7; } { const v4f l = GDN_L4(49, 2); x49 -= l.x * x8; x49 -= l.y * x9; x49 -= l.z * x10; x49 -= l.w * x11; } { const v4f l = GDN_L4(49, 3); x49 -= l.x * x12; x49 -= l.y * x13; x49 -= l.z * x14; x49 -= l.w * x15; } { const v4f l = GDN_L4(49, 4); x49 -= l.x * x16; x49 -= l.y * x17; x49 -= l.z * x18; x49 -= l.w * x19; } { const v4f l = GDN_L4(49, 5); x49 -= l.x * x20; x49 -= l.y * x21; x49 -= l.z * x22; x49 -= l.w * x23; } { const v4f l = GDN_L4(49, 6); x49 -= l.x * x24; x49 -= l.y * x25; x49 -= l.z * x26; x49 -= l.w * x27; } { const v4f l = GDN_L4(49, 7); x49 -= l.x * x28; x49 -= l.y * x29; x49 -= l.z * x30; x49 -= l.w * x31; } { const v4f l = GDN_L4(49, 8); x49 -= l.x * x32; x49 -= l.y * x33; x49 -= l.z * x34; x49 -= l.w * x35; } { const v4f l = GDN_L4(49, 9); x49 -= l.x * x36; x49 -= l.y * x37; x49 -= l.z * x38; x49 -= l.w * x39; } { const v4f l = GDN_L4(49, 10); x49 -= l.x * x40; x49 -= l.y * x41; x49 -= l.z * x42; x49 -= l.w * x43; } { const v4f l = GDN_L4(49, 11); x49 -= l.x * x44; x49 -= l.y * x45; x49 -= l.z * x46; x49 -= l.w * x47; } { const v4f l = GDN_L4(49, 12); x49 -= l.x * x48; } __builtin_amdgcn_sched_barrier(0);
        float x50 = GDN_RHS(50); { const v4f l = GDN_L4(50, 0); x50 -= l.x * x0; x50 -= l.y * x1; x50 -= l.z * x2; x50 -= l.w * x3; } { const v4f l = GDN_L4(50, 1); x50 -= l.x * x4; x50 -= l.y * x5; x50 -= l.z * x6; x50 -= l.w * x7; } { const v4f l = GDN_L4(50, 2); x50 -= l.x * x8; x50 -= l.y * x9; x50 -= l.z * x10; x50 -= l.w * x11; } { const v4f l = GDN_L4(50, 3); x50 -= l.x * x12; x50 -= l.y * x13; x50 -= l.z * x14; x50 -= l.w * x15; } { const v4f l = GDN_L4(50, 4); x50 -= l.x * x16; x50 -= l.y * x17; x50 -= l.z * x18; x50 -= l.w * x19; } { const v4f l = GDN_L4(50, 5); x50 -= l.x * x20; x50 -= l.y * x21; x50 -= l.z * x22; x50 -= l.w * x23; } { const v4f l = GDN_L4(50, 6); x50 -= l.x * x24; x50 -= l.y * x25; x50 -= l.z * x26; x50 -= l.w * x27; } { const v4f l = GDN_L4(50, 7); x50 -= l.x * x28; x50 -= l.y * x29; x50 -= l.z * x30; x50 -= l.w * x31; } { const v4f l = GDN_L4(50, 8); x50 -= l.x * x32; x50 -= l.y * x33; x50 -= l.z * x34; x50 -= l.w * x35; } { const v4f l = GDN_L4(50, 9); x50 -= l.x * x36; x50 -= l.y * x37; x50 -= l.z * x38; x50 -= l.w * x39; } { const v4f l = GDN_L4(50, 10); x50 -= l.x * x40; x50 -= l.y * x41; x50 -= l.z * x42; x50 -= l.w * x43; } { const v4f l = GDN_L4(50, 11); x50 -= l.x * x44; x50 -= l.y * x45; x50 -= l.z * x46; x50 -= l.w * x47; } { const v4f l = GDN_L4(50, 12); x50 -= l.x * x48; x50 -= l.y * x49; } __builtin_amdgcn_sched_barrier(0);
        float x51 = GDN_RHS(51); { const v4f l = GDN_L4(51, 0); x51 -= l.x * x0; x51 -= l.y * x1; x51 -= l.z * x2; x51 -= l.w * x3; } { const v4f l = GDN_L4(51, 1); x51 -= l.x * x4; x51 -= l.y * x5; x51 -= l.z * x6; x51 -= l.w * x7; } { const v4f l = GDN_L4(51, 2); x51 -= l.x * x8; x51 -= l.y * x9; x51 -= l.z * x10; x51 -= l.w * x11; } { const v4f l = GDN_L4(51, 3); x51 -= l.x * x12; x51 -= l.y * x13; x51 -= l.z * x14; x51 -= l.w * x15; } { const v4f l = GDN_L4(51, 4); x51 -= l.x * x16; x51 -= l.y * x17; x51 -= l.z * x18; x51 -= l.w * x19; } { const v4f l = GDN_L4(51, 5); x51 -= l.x * x20; x51 -= l.y * x21; x51 -= l.z * x22; x51 -= l.w * x23; } { const v4f l = GDN_L4(51, 6); x51 -= l.x * x24; x51 -= l.y * x25; x51 -= l.z * x26; x51 -= l.w * x27; } { const v4f l = GDN_L4(51, 7); x51 -= l.x * x28; x51 -= l.y * x29; x51 -= l.z * x30; x51 -= l.w * x31; } { const v4f l = GDN_L4(51, 8); x51 -= l.x * x32; x51 -= l.y * x33; x51 -= l.z * x34; x51 -= l.w * x35; } { const v4f l = GDN_L4(51, 9); x51 -= l.x * x36; x51 -= l.y * x37; x51 -= l.z * x38; x51 -= l.w * x39; } { const v4f l = GDN_L4(51, 10); x51 -= l.x * x40; x51 -= l.y * x41; x51 -= l.z * x42; x51 -= l.w * x43; } { const v4f l = GDN_L4(51, 11); x51 -= l.x * x44; x51 -= l.y * x45; x51 -= l.z * x46; x51 -= l.w * x47; } { const v4f l = GDN_L4(51, 12); x51 -= l.x * x48; x51 -= l.y * x49; x51 -= l.z * x50; } __builtin_amdgcn_sched_barrier(0);
        float x52 = GDN_RHS(52); { const v4f l = GDN_L4(52, 0); x52 -= l.x * x0; x52 -= l.y * x1; x52 -= l.z * x2; x52 -= l.w * x3; } { const v4f l = GDN_L4(52, 1); x52 -= l.x * x4; x52 -= l.y * x5; x52 -= l.z * x6; x52 -= l.w * x7; } { const v4f l = GDN_L4(52, 2); x52 -= l.x * x8; x52 -= l.y * x9; x52 -= l.z * x10; x52 -= l.w * x11; } { const v4f l = GDN_L4(52, 3); x52 -= l.x * x12; x52 -= l.y * x13; x52 -= l.z * x14; x52 -= l.w * x15; } { const v4f l = GDN_L4(52, 4); x52 -= l.x * x16; x52 -= l.y * x17; x52 -= l.z * x18; x52 -= l.w * x19; } { const v4f l = GDN_L4(52, 5); x52 -= l.x * x20; x52 -= l.y * x21; x52 -= l.z * x22; x52 -= l.w * x23; } { const v4f l = GDN_L4(52, 6); x52 -= l.x * x24; x52 -= l.y * x25; x52 -= l.z * x26; x52 -= l.w * x27; } { const v4f l = GDN_L4(52, 7); x52 -= l.x * x28; x52 -= l.y * x29; x52 -= l.z * x30; x52 -= l.w * x31; } { const v4f l = GDN_L4(52, 8); x52 -= l.x * x32; x52 -= l.y * x33; x52 -= l.z * x34; x52 -= l.w * x35; } { const v4f l = GDN_L4(52, 9); x52 -= l.x * x36; x52 -= l.y * x37; x52 -= l.z * x38; x52 -= l.w * x39; } { const v4f l = GDN_L4(52, 10); x52 -= l.x * x40; x52 -= l.y * x41; x52 -= l.z * x42; x52 -= l.w * x43; } { const v4f l = GDN_L4(52, 11); x52 -= l.x * x44; x52 -= l.y * x45; x52 -= l.z * x46; x52 -= l.w * x47; } { const v4f l = GDN_L4(52, 12); x52 -= l.x * x48; x52 -= l.y * x49; x52 -= l.z * x50; x52 -= l.w * x51; } __builtin_amdgcn_sched_barrier(0);
        float x53 = GDN_RHS(53); { const v4f l = GDN_L4(53, 0); x53 -= l.x * x0; x53 -= l.y * x1; x53 -= l.z * x2; x53 -= l.w * x3; } { const v4f l = GDN_L4(53, 1); x53 -= l.x * x4; x53 -= l.y * x5; x53 -= l.z * x6; x53 -= l.w * x7; } { const v4f l = GDN_L4(53, 2); x53 -= l.x * x8; x53 -= l.y * x9; x53 -= l.z * x10; x53 -= l.w * x11; } { const v4f l = GDN_L4(53, 3); x53 -= l.x * x12; x53 -= l.y * x13; x53 -= l.z * x14; x53 -= l.w * x15; } { const v4f l = GDN_L4(53, 4); x53 -= l.x * x16; x53 -= l.y * x17; x53 -= l.z * x18; x53 -= l.w * x19; } { const v4f l = GDN_L4(53, 5); x53 -= l.x * x20; x53 -= l.y * x21; x53 -= l.z * x22; x53 -= l.w * x23; } { const v4f l = GDN_L4(53, 6); x53 -= l.x * x24; x53 -= l.y * x25; x53 -= l.z * x26; x53 -= l.w * x27; } { const v4f l = GDN_L4(53, 7); x53 -= l.x * x28; x53 -= l.y * x29; x53 -= l.z * x30; x53 -= l.w * x31; } { const v4f l = GDN_L4(53, 8); x53 -= l.x * x32; x53 -= l.y * x33; x53 -= l.z * x34; x53 -= l.w * x35; } { const v4f l = GDN_L4(53, 9); x53 -= l.x * x36; x53 -= l.y * x37; x53 -= l.z * x38; x53 -= l.w * x39; } { const v4f l = GDN_L4(53, 10); x53 -= l.x * x40; x53 -= l.y * x41; x53 -= l.z * x42; x53 -= l.w * x43; } { const v4f l = GDN_L4(53, 11); x53 -= l.x * x44; x53 -= l.y * x45; x53 -= l.z * x46; x53 -= l.w * x47; } { const v4f l = GDN_L4(53, 12); x53 -= l.x * x48; x53 -= l.y * x49; x53 -= l.z * x50; x53 -= l.w * x51; } { const v4f l = GDN_L4(53, 13); x53 -= l.x * x52; } __builtin_amdgcn_sched_barrier(0);
        float x54 = GDN_RHS(54); { const v4f l = GDN_L4(54, 0); x54 -= l.x * x0; x54 -= l.y * x1; x54 -= l.z * x2; x54 -= l.w * x3; } { const v4f l = GDN_L4(54, 1); x54 -= l.x * x4; x54 -= l.y * x5; x54 -= l.z * x6; x54 -= l.w * x7; } { const v4f l = GDN_L4(54, 2); x54 -= l.x * x8; x54 -= l.y * x9; x54 -= l.z * x10; x54 -= l.w * x11; } { const v4f l = GDN_L4(54, 3); x54 -= l.x * x12; x54 -= l.y * x13; x54 -= l.z * x14; x54 -= l.w * x15; } { const v4f l = GDN_L4(54, 4); x54 -= l.x * x16; x54 -= l.y * x17; x54 -= l.z * x18; x54 -= l.w * x19; } { const v4f l = GDN_L4(54, 5); x54 -= l.x * x20; x54 -= l.y * x21; x54 -= l.z * x22; x54 -= l.w * x23; } { const v4f l = GDN_L4(54, 6); x54 -= l.x * x24; x54 -= l.y * x25; x54 -= l.z * x26; x54 -= l.w * x27; } { const v4f l = GDN_L4(54, 7); x54 -= l.x * x28; x54 -= l.y * x29; x54 -= l.z * x30; x54 -= l.w * x31; } { const v4f l = GDN_L4(54, 8); x54 -= l.x * x32; x54 -= l.y * x33; x54 -= l.z * x34; x54 -= l.w * x35; } { const v4f l = GDN_L4(54, 9); x54 -= l.x * x36; x54 -= l.y * x37; x54 -= l.z * x38; x54 -= l.w * x39; } { const v4f l = GDN_L4(54, 10); x54 -= l.x * x40; x54 -= l.y * x41; x54 -= l.z * x42; x54 -= l.w * x43; } { const v4f l = GDN_L4(54, 11); x54 -= l.x * x44; x54 -= l.y * x45; x54 -= l.z * x46; x54 -= l.w * x47; } { const v4f l = GDN_L4(54, 12); x54 -= l.x * x48; x54 -= l.y * x49; x54 -= l.z * x50; x54 -= l.w * x51; } { const v4f l = GDN_L4(54, 13); x54 -= l.x * x52; x54 -= l.y * x53; } __builtin_amdgcn_sched_barrier(0);
        float x55 = GDN_RHS(55); { const v4f l = GDN_L4(55, 0); x55 -= l.x * x0; x55 -= l.y * x1; x55 -= l.z * x2; x55 -= l.w * x3; } { const v4f l = GDN_L4(55, 1); x55 -= l.x * x4; x55 -= l.y * x5; x55 -= l.z * x6; x55 -= l.w * x7; } { const v4f l = GDN_L4(55, 2); x55 -= l.x * x8; x55 -= l.y * x9; x55 -= l.z * x10; x55 -= l.w * x11; } { const v4f l = GDN_L4(55, 3); x55 -= l.x * x12; x55 -= l.y * x13; x55 -= l.z * x14; x55 -= l.w * x15; } { const v4f l = GDN_L4(55, 4); x55 -= l.x * x16; x55 -= l.y * x17; x55 -= l.z * x18; x55 -= l.w * x19; } { const v4f l = GDN_L4(55, 5); x55 -= l.x * x20; x55 -= l.y * x21; x55 -= l.z * x22; x55 -= l.w * x23; } { const v4f l = GDN_L4(55, 6); x55 -= l.x * x24; x55 -= l.y * x25; x55 -= l.z * x26; x55 -= l.w * x27; } { const v4f l = GDN_L4(55, 7); x55 -= l.x * x28; x55 -= l.y * x29; x55 -= l.z * x30; x55 -= l.w * x31; } { const v4f l = GDN_L4(55, 8); x55 -= l.x * x32; x55 -= l.y * x33; x55 -= l.z * x34; x55 -= l.w * x35; } { const v4f l = GDN_L4(55, 9); x55 -= l.x * x36; x55 -= l.y * x37; x55 -= l.z * x38; x55 -= l.w * x39; } { const v4f l = GDN_L4(55, 10); x55 -= l.x * x40; x55 -= l.y * x41; x55 -= l.z * x42; x55 -= l.w * x43; } { const v4f l = GDN_L4(55, 11); x55 -= l.x * x44; x55 -= l.y * x45; x55 -= l.z * x46; x55 -= l.w * x47; } { const v4f l = GDN_L4(55, 12); x55 -= l.x * x48; x55 -= l.y * x49; x55 -= l.z * x50; x55 -= l.w * x51; } { const v4f l = GDN_L4(55, 13); x55 -= l.x * x52; x55 -= l.y * x53; x55 -= l.z * x54; } __builtin_amdgcn_sched_barrier(0);
        float x56 = GDN_RHS(56); { const v4f l = GDN_L4(56, 0); x56 -= l.x * x0; x56 -= l.y * x1; x56 -= l.z * x2; x56 -= l.w * x3; } { const v4f l = GDN_L4(56, 1); x56 -= l.x * x4; x56 -= l.y * x5; x56 -= l.z * x6; x56 -= l.w * x7; } { const v4f l = GDN_L4(56, 2); x56 -= l.x * x8; x56 -= l.y * x9; x56 -= l.z * x10; x56 -= l.w * x11; } { const v4f l = GDN_L4(56, 3); x56 -= l.x * x12; x56 -= l.y * x13; x56 -= l.z * x14; x56 -= l.w * x15; } { const v4f l = GDN_L4(56, 4); x56 -= l.x * x16; x56 -= l.y * x17; x56 -= l.z * x18; x56 -= l.w * x19; } { const v4f l = GDN_L4(56, 5); x56 -= l.x * x20; x56 -= l.y * x21; x56 -= l.z * x22; x56 -= l.w * x23; } { const v4f l = GDN_L4(56, 6); x56 -= l.x * x24; x56 -= l.y * x25; x56 -= l.z * x26; x56 -= l.w * x27; } { const v4f l = GDN_L4(56, 7); x56 -= l.x * x28; x56 -= l.y * x29; x56 -= l.z * x30; x56 -= l.w * x31; } { const v4f l = GDN_L4(56, 8); x56 -= l.x * x32; x56 -= l.y * x33; x56 -= l.z * x34; x56 -= l.w * x35; } { const v4f l = GDN_L4(56, 9); x56 -= l.x * x36; x56 -= l.y * x37; x56 -= l.z * x38; x56 -= l.w * x39; } { const v4f l = GDN_L4(56, 10); x56 -= l.x * x40; x56 -= l.y * x41; x56 -= l.z * x42; x56 -= l.w * x43; } { const v4f l = GDN_L4(56, 11); x56 -= l.x * x44; x56 -= l.y * x45; x56 -= l.z * x46; x56 -= l.w * x47; } { const v4f l = GDN_L4(56, 12); x56 -= l.x * x48; x56 -= l.y * x49; x56 -= l.z * x50; x56 -= l.w * x51; } { const v4f l = GDN_L4(56, 13); x56 -= l.x * x52; x56 -= l.y * x53; x56 -= l.z * x54; x56 -= l.w * x55; } __builtin_amdgcn_sched_barrier(0);
        float x57 = GDN_RHS(57); { const v4f l = GDN_L4(57, 0); x57 -= l.x * x0; x57 -= l.y * x1; x57 -= l.z * x2; x57 -= l.w * x3; } { const v4f l = GDN_L4(57, 1); x57 -= l.x * x4; x57 -= l.y * x5; x57 -= l.z * x6; x57 -= l.w * x7; } { const v4f l = GDN_L4(57, 2); x57 -= l.x * x8; x57 -= l.y * x9; x57 -= l.z * x10; x57 -= l.w * x11; } { const v4f l = GDN_L4(57, 3); x57 -= l.x * x12; x57 -= l.y * x13; x57 -= l.z * x14; x57 -= l.w * x15; } { const v4f l = GDN_L4(57, 4); x57 -= l.x * x16; x57 -= l.y * x17; x57 -= l.z * x18; x57 -= l.w * x19; } { const v4f l = GDN_L4(57, 5); x57 -= l.x * x20; x57 -= l.y * x21; x57 -= l.z * x22; x57 -= l.w * x23; } { const v4f l = GDN_L4(57, 6); x57 -= l.x * x24; x57 -= l.y * x25; x57 -= l.z * x26; x57 -= l.w * x27; } { const v4f l = GDN_L4(57, 7); x57 -= l.x * x28; x57 -= l.y * x29; x57 -= l.z * x30; x57 -= l.w * x31; } { const v4f l = GDN_L4(57, 8); x57 -= l.x * x32; x57 -= l.y * x33; x57 -= l.z * x34; x57 -= l.w * x35; } { const v4f l = GDN_L4(57, 9); x57 -= l.x * x36; x57 -= l.y * x37; x57 -= l.z * x38; x57 -= l.w * x39; } { const v4f l = GDN_L4(57, 10); x57 -= l.x * x40; x57 -= l.y * x41; x57 -= l.z * x42; x57 -= l.w * x43; } { const v4f l = GDN_L4(57, 11); x57 -= l.x * x44; x57 -= l.y * x45; x57 -= l.z * x46; x57 -= l.w * x47; } { const v4f l = GDN_L4(57, 12); x57 -= l.x * x48; x57 -= l.y * x49; x57 -= l.z * x50; x57 -= l.w * x51; } { const v4f l = GDN_L4(57, 13); x57 -= l.x * x52; x57 -= l.y * x53; x57 -= l.z * x54; x57 -= l.w * x55; } { const v4f l = GDN_L4(57, 14); x57 -= l.x * x56; } __builtin_amdgcn_sched_barrier(0);
        float x58 = GDN_RHS(58); { const v4f l = GDN_L4(58, 0); x58 -= l.x * x0; x58 -= l.y * x1; x58 -= l.z * x2; x58 -= l.w * x3; } { const v4f l = GDN_L4(58, 1); x58 -= l.x * x4; x58 -= l.y * x5; x58 -= l.z * x6; x58 -= l.w * x7; } { const v4f l = GDN_L4(58, 2); x58 -= l.x * x8; x58 -= l.y * x9; x58 -= l.z * x10; x58 -= l.w * x11; } { const v4f l = GDN_L4(58, 3); x58 -= l.x * x12; x58 -= l.y * x13; x58 -= l.z * x14; x58 -= l.w * x15; } { const v4f l = GDN_L4(58, 4); x58 -= l.x * x16; x58 -= l.y * x17; x58 -= l.z * x18; x58 -= l.w * x19; } { const v4f l = GDN_L4(58, 5); x58 -= l.x * x20; x58 -= l.y * x21; x58 -= l.z * x22; x58 -= l.w * x23; } { const v4f l = GDN_L4(58, 6); x58 -= l.x * x24; x58 -= l.y * x25; x58 -= l.z * x26; x58 -= l.w * x27; } { const v4f l = GDN_L4(58, 7); x58 -= l.x * x28; x58 -= l.y * x29; x58 -= l.z * x30; x58 -= l.w * x31; } { const v4f l = GDN_L4(58, 8); x58 -= l.x * x32; x58 -= l.y * x33; x58 -= l.z * x34; x58 -= l.w * x35; } { const v4f l = GDN_L4(58, 9); x58 -= l.x * x36; x58 -= l.y * x37; x58 -= l.z * x38; x58 -= l.w * x39; } { const v4f l = GDN_L4(58, 10); x58 -= l.x * x40; x58 -= l.y * x41; x58 -= l.z * x42; x58 -= l.w * x43; } { const v4f l = GDN_L4(58, 11); x58 -= l.x * x44; x58 -= l.y * x45; x58 -= l.z * x46; x58 -= l.w * x47; } { const v4f l = GDN_L4(58, 12); x58 -= l.x * x48; x58 -= l.y * x49; x58 -= l.z * x50; x58 -= l.w * x51; } { const v4f l = GDN_L4(58, 13); x58 -= l.x * x52; x58 -= l.y * x53; x58 -= l.z * x54; x58 -= l.w * x55; } { const v4f l = GDN_L4(58, 14); x58 -= l.x * x56; x58 -= l.y * x57; } __builtin_amdgcn_sched_barrier(0);
        float x59 = GDN_RHS(59); { const v4f l = GDN_L4(59, 0); x59 -= l.x * x0; x59 -= l.y * x1; x59 -= l.z * x2; x59 -= l.w * x3; } { const v4f l = GDN_L4(59, 1); x59 -= l.x * x4; x59 -= l.y * x5; x59 -= l.z * x6; x59 -= l.w * x7; } { const v4f l = GDN_L4(59, 2); x59 -= l.x * x8; x59 -= l.y * x9; x59 -= l.z * x10; x59 -= l.w * x11; } { const v4f l = GDN_L4(59, 3); x59 -= l.x * x12; x59 -= l.y * x13; x59 -= l.z * x14; x59 -= l.w * x15; } { const v4f l = GDN_L4(59, 4); x59 -= l.x * x16; x59 -= l.y * x17; x59 -= l.z * x18; x59 -= l.w * x19; } { const v4f l = GDN_L4(59, 5); x59 -= l.x * x20; x59 -= l.y * x21; x59 -= l.z * x22; x59 -= l.w * x23; } { const v4f l = GDN_L4(59, 6); x59 -= l.x * x24; x59 -= l.y * x25; x59 -= l.z * x26; x59 -= l.w * x27; } { const v4f l = GDN_L4(59, 7); x59 -= l.x * x28; x59 -= l.y * x29; x59 -= l.z * x30; x59 -= l.w * x31; } { const v4f l = GDN_L4(59, 8); x59 -= l.x * x32; x59 -= l.y * x33; x59 -= l.z * x34; x59 -= l.w * x35; } { const v4f l = GDN_L4(59, 9); x59 -= l.x * x36; x59 -= l.y * x37; x59 -= l.z * x38; x59 -= l.w * x39; } { const v4f l = GDN_L4(59, 10); x59 -= l.x * x40; x59 -= l.y * x41; x59 -= l.z * x42; x59 -= l.w * x43; } { const v4f l = GDN_L4(59, 11); x59 -= l.x * x44; x59 -= l.y * x45; x59 -= l.z * x46; x59 -= l.w * x47; } { const v4f l = GDN_L4(59, 12); x59 -= l.x * x48; x59 -= l.y * x49; x59 -= l.z * x50; x59 -= l.w * x51; } { const v4f l = GDN_L4(59, 13); x59 -= l.x * x52; x59 -= l.y * x53; x59 -= l.z * x54; x59 -= l.w * x55; } { const v4f l = GDN_L4(59, 14); x59 -= l.x * x56; x59 -= l.y * x57; x59 -= l.z * x58; } __builtin_amdgcn_sched_barrier(0);
        float x60 = GDN_RHS(60); { const v4f l = GDN_L4(60, 0); x60 -= l.x * x0; x60 -= l.y * x1; x60 -= l.z * x2; x60 -= l.w * x3; } { const v4f l = GDN_L4(60, 1); x60 -= l.x * x4; x60 -= l.y * x5; x60 -= l.z * x6; x60 -= l.w * x7; } { const v4f l = GDN_L4(60, 2); x60 -= l.x * x8; x60 -= l.y * x9; x60 -= l.z * x10; x60 -= l.w * x11; } { const v4f l = GDN_L4(60, 3); x60 -= l.x * x12; x60 -= l.y * x13; x60 -= l.z * x14; x60 -= l.w * x15; } { const v4f l = GDN_L4(60, 4); x60 -= l.x * x16; x60 -= l.y * x17; x60 -= l.z * x18; x60 -= l.w * x19; } { const v4f l = GDN_L4(60, 5); x60 -= l.x * x20; x60 -= l.y * x21; x60 -= l.z * x22; x60 -= l.w * x23; } { const v4f l = GDN_L4(60, 6); x60 -= l.x * x24; x60 -= l.y * x25; x60 -= l.z * x26; x60 -= l.w * x27; } { const v4f l = GDN_L4(60, 7); x60 -= l.x * x28; x60 -= l.y * x29; x60 -= l.z * x30; x60 -= l.w * x31; } { const v4f l = GDN_L4(60, 8); x60 -= l.x * x32; x60 -= l.y * x33; x60 -= l.z * x34; x60 -= l.w * x35; } { const v4f l = GDN_L4(60, 9); x60 -= l.x * x36; x60 -= l.y * x37; x60 -= l.z * x38; x60 -= l.w * x39; } { const v4f l = GDN_L4(60, 10); x60 -= l.x * x40; x60 -= l.y * x41; x60 -= l.z * x42; x60 -= l.w * x43; } { const v4f l = GDN_L4(60, 11); x60 -= l.x * x44; x60 -= l.y * x45; x60 -= l.z * x46; x60 -= l.w * x47; } { const v4f l = GDN_L4(60, 12); x60 -= l.x * x48; x60 -= l.y * x49; x60 -= l.z * x50; x60 -= l.w * x51; } { const v4f l = GDN_L4(60, 13); x60 -= l.x * x52; x60 -= l.y * x53; x60 -= l.z * x54; x60 -= l.w * x55; } { const v4f l = GDN_L4(60, 14); x60 -= l.x * x56; x60 -= l.y * x57; x60 -= l.z * x58; x60 -= l.w * x59; } __builtin_amdgcn_sched_barrier(0);
        float x61 = GDN_RHS(61); { const v4f l = GDN_L4(61, 0); x61 -= l.x * x0; x61 -= l.y * x1; x61 -= l.z * x2; x61 -= l.w * x3; } { const v4f l = GDN_L4(61, 1); x61 -= l.x * x4; x61 -= l.y * x5; x61 -= l.z * x6; x61 -= l.w * x7; } { const v4f l = GDN_L4(61, 2); x61 -= l.x * x8; x61 -= l.y * x9; x61 -= l.z * x10; x61 -= l.w * x11; } { const v4f l = GDN_L4(61, 3); x61 -= l.x * x12; x61 -= l.y * x13; x61 -= l.z * x14; x61 -= l.w * x15; } { const v4f l = GDN_L4(61, 4); x61 -= l.x * x16; x61 -= l.y * x17; x61 -= l.z * x18; x61 -= l.w * x19; } { const v4f l = GDN_L4(61, 5); x61 -= l.x * x20; x61 -= l.y * x21; x61 -= l.z * x22; x61 -= l.w * x23; } { const v4f l = GDN_L4(61, 6); x61 -= l.x * x24; x61 -= l.y * x25; x61 -= l.z * x26; x61 -= l.w * x27; } { const v4f l = GDN_L4(61, 7); x61 -= l.x * x28; x61 -= l.y * x29; x61 -= l.z * x30; x61 -= l.w * x31; } { const v4f l = GDN_L4(61, 8); x61 -= l.x * x32; x61 -= l.y * x33; x61 -= l.z * x34; x61 -= l.w * x35; } { const v4f l = GDN_L4(61, 9); x61 -= l.x * x36; x61 -= l.y * x37; x61 -= l.z * x38; x61 -= l.w * x39; } { const v4f l = GDN_L4(61, 10); x61 -= l.x * x40; x61 -= l.y * x41; x61 -= l.z * x42; x61 -= l.w * x43; } { const v4f l = GDN_L4(61, 11); x61 -= l.x * x44; x61 -= l.y * x45; x61 -= l.z * x46; x61 -= l.w * x47; } { const v4f l = GDN_L4(61, 12); x61 -= l.x * x48; x61 -= l.y * x49; x61 -= l.z * x50; x61 -= l.w * x51; } { const v4f l = GDN_L4(61, 13); x61 -= l.x * x52; x61 -= l.y * x53; x61 -= l.z * x54; x61 -= l.w * x55; } { const v4f l = GDN_L4(61, 14); x61 -= l.x * x56; x61 -= l.y * x57; x61 -= l.z * x58; x61 -= l.w * x59; } { const v4f l = GDN_L4(61, 15); x61 -= l.x * x60; } __builtin_amdgcn_sched_barrier(0);
        float x62 = GDN_RHS(62); { const v4f l = GDN_L4(62, 0); x62 -= l.x * x0; x62 -= l.y * x1; x62 -= l.z * x2; x62 -= l.w * x3; } { const v4f l = GDN_L4(62, 1); x62 -= l.x * x4; x62 -= l.y * x5; x62 -= l.z * x6; x62 -= l.w * x7; } { const v4f l = GDN_L4(62, 2); x62 -= l.x * x8; x62 -= l.y * x9; x62 -= l.z * x10; x62 -= l.w * x11; } { const v4f l = GDN_L4(62, 3); x62 -= l.x * x12; x62 -= l.y * x13; x62 -= l.z * x14; x62 -= l.w * x15; } { const v4f l = GDN_L4(62, 4); x62 -= l.x * x16; x62 -= l.y * x17; x62 -= l.z * x18; x62 -= l.w * x19; } { const v4f l = GDN_L4(62, 5); x62 -= l.x * x20; x62 -= l.y * x21; x62 -= l.z * x22; x62 -= l.w * x23; } { const v4f l = GDN_L4(62, 6); x62 -= l.x * x24; x62 -= l.y * x25; x62 -= l.z * x26; x62 -= l.w * x27; } { const v4f l = GDN_L4(62, 7); x62 -= l.x * x28; x62 -= l.y * x29; x62 -= l.z * x30; x62 -= l.w * x31; } { const v4f l = GDN_L4(62, 8); x62 -= l.x * x32; x62 -= l.y * x33; x62 -= l.z * x34; x62 -= l.w * x35; } { const v4f l = GDN_L4(62, 9); x62 -= l.x * x36; x62 -= l.y * x37; x62 -= l.z * x38; x62 -= l.w * x39; } { const v4f l = GDN_L4(62, 10); x62 -= l.x * x40; x62 -= l.y * x41; x62 -= l.z * x42; x62 -= l.w * x43; } { const v4f l = GDN_L4(62, 11); x62 -= l.x * x44; x62 -= l.y * x45; x62 -= l.z * x46; x62 -= l.w * x47; } { const v4f l = GDN_L4(62, 12); x62 -= l.x * x48; x62 -= l.y * x49; x62 -= l.z * x50; x62 -= l.w * x51; } { const v4f l = GDN_L4(62, 13); x62 -= l.x * x52; x62 -= l.y * x53; x62 -= l.z * x54; x62 -= l.w * x55; } { const v4f l = GDN_L4(62, 14); x62 -= l.x * x56; x62 -= l.y * x57; x62 -= l.z * x58; x62 -= l.w * x59; } { const v4f l = GDN_L4(62, 15); x62 -= l.x * x60; x62 -= l.y * x61; } __builtin_amdgcn_sched_barrier(0);
        float x63 = GDN_RHS(63); { const v4f l = GDN_L4(63, 0); x63 -= l.x * x0; x63 -= l.y * x1; x63 -= l.z * x2; x63 -= l.w * x3; } { const v4f l = GDN_L4(63, 1); x63 -= l.x * x4; x63 -= l.y * x5; x63 -= l.z * x6; x63 -= l.w * x7; } { const v4f l = GDN_L4(63, 2); x63 -= l.x * x8; x63 -= l.y * x9; x63 -= l.z * x10; x63 -= l.w * x11; } { const v4f l = GDN_L4(63, 3); x63 -= l.x * x12; x63 -= l.y * x13; x63 -= l.z * x14; x63 -= l.w * x15; } { const v4f l = GDN_L4(63, 4); x63 -= l.x * x16; x63 -= l.y * x17; x63 -= l.z * x18; x63 -= l.w * x19; } { const v4f l = GDN_L4(63, 5); x63 -= l.x * x20; x63 -= l.y * x21; x63 -= l.z * x22; x63 -= l.w * x23; } { const v4f l = GDN_L4(63, 6); x63 -= l.x * x24; x63 -= l.y * x25; x63 -= l.z * x26; x63 -= l.w * x27; } { const v4f l = GDN_L4(63, 7); x63 -= l.x * x28; x63 -= l.y * x29; x63 -= l.z * x30; x63 -= l.w * x31; } { const v4f l = GDN_L4(63, 8); x63 -= l.x * x32; x63 -= l.y * x33; x63 -= l.z * x34; x63 -= l.w * x35; } { const v4f l = GDN_L4(63, 9); x63 -= l.x * x36; x63 -= l.y * x37; x63 -= l.z * x38; x63 -= l.w * x39; } { const v4f l = GDN_L4(63, 10); x63 -= l.x * x40; x63 -= l.y * x41; x63 -= l.z * x42; x63 -= l.w * x43; } { const v4f l = GDN_L4(63, 11); x63 -= l.x * x44; x63 -= l.y * x45; x63 -= l.z * x46; x63 -= l.w * x47; } { const v4f l = GDN_L4(63, 12); x63 -= l.x * x48; x63 -= l.y * x49; x63 -= l.z * x50; x63 -= l.w * x51; } { const v4f l = GDN_L4(63, 13); x63 -= l.x * x52; x63 -= l.y * x53; x63 -= l.z * x54; x63 -= l.w * x55; } { const v4f l = GDN_L4(63, 14); x63 -= l.x * x56; x63 -= l.y * x57; x63 -= l.z * x58; x63 -= l.w * x59; } { const v4f l = GDN_L4(63, 15); x63 -= l.x * x60; x63 -= l.y * x61; x63 -= l.z * x62; } __builtin_amdgcn_sched_barrier(0);
        if (c < 128) { GU[0 * 128 + c] = x0; GU[1 * 128 + c] = x1; GU[2 * 128 + c] = x2; GU[3 * 128 + c] = x3; GU[4 * 128 + c] = x4; GU[5 * 128 + c] = x5; GU[6 * 128 + c] = x6; GU[7 * 128 + c] = x7; GU[8 * 128 + c] = x8; GU[9 * 128 + c] = x9; GU[10 * 128 + c] = x10; GU[11 * 128 + c] = x11; GU[12 * 128 + c] = x12; GU[13 * 128 + c] = x13; GU[14 * 128 + c] = x14; GU[15 * 128 + c] = x15; GU[16 * 128 + c] = x16; GU[17 * 128 + c] = x17; GU[18 * 128 + c] = x18; GU[19 * 128 + c] = x19; GU[20 * 128 + c] = x20; GU[21 * 128 + c] = x21; GU[22 * 128 + c] = x22; GU[23 * 128 + c] = x23; GU[24 * 128 + c] = x24; GU[25 * 128 + c] = x25; GU[26 * 128 + c] = x26; GU[27 * 128 + c] = x27; GU[28 * 128 + c] = x28; GU[29 * 128 + c] = x29; GU[30 * 128 + c] = x30; GU[31 * 128 + c] = x31; GU[32 * 128 + c] = x32; GU[33 * 128 + c] = x33; GU[34 * 128 + c] = x34; GU[35 * 128 + c] = x35; GU[36 * 128 + c] = x36; GU[37 * 128 + c] = x37; GU[38 * 128 + c] = x38; GU[39 * 128 + c] = x39; GU[40 * 128 + c] = x40; GU[41 * 128 + c] = x41; GU[42 * 128 + c] = x42; GU[43 * 128 + c] = x43; GU[44 * 128 + c] = x44; GU[45 * 128 + c] = x45; GU[46 * 128 + c] = x46; GU[47 * 128 + c] = x47; GU[48 * 128 + c] = x48; GU[49 * 128 + c] = x49; GU[50 * 128 + c] = x50; GU[51 * 128 + c] = x51; GU[52 * 128 + c] = x52; GU[53 * 128 + c] = x53; GU[54 * 128 + c] = x54; GU[55 * 128 + c] = x55; GU[56 * 128 + c] = x56; GU[57 * 128 + c] = x57; GU[58 * 128 + c] = x58; GU[59 * 128 + c] = x59; GU[60 * 128 + c] = x60; GU[61 * 128 + c] = x61; GU[62 * 128 + c] = x62; GU[63 * 128 + c] = x63; }
        else { GNW[0 * 128 + (c - 128)] = (bf16)f2bf(-x0); GNW[1 * 128 + (c - 128)] = (bf16)f2bf(-x1); GNW[2 * 128 + (c - 128)] = (bf16)f2bf(-x2); GNW[3 * 128 + (c - 128)] = (bf16)f2bf(-x3); GNW[4 * 128 + (c - 128)] = (bf16)f2bf(-x4); GNW[5 * 128 + (c - 128)] = (bf16)f2bf(-x5); GNW[6 * 128 + (c - 128)] = (bf16)f2bf(-x6); GNW[7 * 128 + (c - 128)] = (bf16)f2bf(-x7); GNW[8 * 128 + (c - 128)] = (bf16)f2bf(-x8); GNW[9 * 128 + (c - 128)] = (bf16)f2bf(-x9); GNW[10 * 128 + (c - 128)] = (bf16)f2bf(-x10); GNW[11 * 128 + (c - 128)] = (bf16)f2bf(-x11); GNW[12 * 128 + (c - 128)] = (bf16)f2bf(-x12); GNW[13 * 128 + (c - 128)] = (bf16)f2bf(-x13); GNW[14 * 128 + (c - 128)] = (bf16)f2bf(-x14); GNW[15 * 128 + (c - 128)] = (bf16)f2bf(-x15); GNW[16 * 128 + (c - 128)] = (bf16)f2bf(-x16); GNW[17 * 128 + (c - 128)] = (bf16)f2bf(-x17); GNW[18 * 128 + (c - 128)] = (bf16)f2bf(-x18); GNW[19 * 128 + (c - 128)] = (bf16)f2bf(-x19); GNW[20 * 128 + (c - 128)] = (bf16)f2bf(-x20); GNW[21 * 128 + (c - 128)] = (bf16)f2bf(-x21); GNW[22 * 128 + (c - 128)] = (bf16)f2bf(-x22); GNW[23 * 128 + (c - 128)] = (bf16)f2bf(-x23); GNW[24 * 128 + (c - 128)] = (bf16)f2bf(-x24); GNW[25 * 128 + (c - 128)] = (bf16)f2bf(-x25); GNW[26 * 128 + (c - 128)] = (bf16)f2bf(-x26); GNW[27 * 128 + (c - 128)] = (bf16)f2bf(-x27); GNW[28 * 128 + (c - 128)] = (bf16)f2bf(-x28); GNW[29 * 128 + (c - 128)] = (bf16)f2bf(-x29); GNW[30 * 128 + (c - 128)] = (bf16)f2bf(-x30); GNW[31 * 128 + (c - 128)] = (bf16)f2bf(-x31); GNW[32 * 128 + (c - 128)] = (bf16)f2bf(-x32); GNW[33 * 128 + (c - 128)] = (bf16)f2bf(-x33); GNW[34 * 128 + (c - 128)] = (bf16)f2bf(-x34); GNW[35 * 128 + (c - 128)] = (bf16)f2bf(-x35); GNW[36 * 128 + (c - 128)] = (bf16)f2bf(-x36); GNW[37 * 128 + (c - 128)] = (bf16)f2bf(-x37); GNW[38 * 128 + (c - 128)] = (bf16)f2bf(-x38); GNW[39 * 128 + (c - 128)] = (bf16)f2bf(-x39); GNW[40 * 128 + (c - 128)] = (bf16)f2bf(-x40); GNW[41 * 128 + (c - 128)] = (bf16)f2bf(-x41); GNW[42 * 128 + (c - 128)] = (bf16)f2bf(-x42); GNW[43 * 128 + (c - 128)] = (bf16)f2bf(-x43); GNW[44 * 128 + (c - 128)] = (bf16)f2bf(-x44); GNW[45 * 128 + (c - 128)] = (bf16)f2bf(-x45); GNW[46 * 128 + (c - 128)] = (bf16)f2bf(-x46); GNW[47 * 128 + (c - 128)] = (bf16)f2bf(-x47); GNW[48 * 128 + (c - 128)] = (bf16)f2bf(-x48); GNW[49 * 128 + (c - 128)] = (bf16)f2bf(-x49); GNW[50 * 128 + (c - 128)] = (bf16)f2bf(-x50); GNW[51 * 128 + (c - 128)] = (bf16)f2bf(-x51); GNW[52 * 128 + (c - 128)] = (bf16)f2bf(-x52); GNW[53 * 128 + (c - 128)] = (bf16)f2bf(-x53); GNW[54 * 128 + (c - 128)] = (bf16)f2bf(-x54); GNW[55 * 128 + (c - 128)] = (bf16)f2bf(-x55); GNW[56 * 128 + (c - 128)] = (bf16)f2bf(-x56); GNW[57 * 128 + (c - 128)] = (bf16)f2bf(-x57); GNW[58 * 128 + (c - 128)] = (bf16)f2bf(-x58); GNW[59 * 128 + (c - 128)] = (bf16)f2bf(-x59); GNW[60 * 128 + (c - 128)] = (bf16)f2bf(-x60); GNW[61 * 128 + (c - 128)] = (bf16)f2bf(-x61); GNW[62 * 128 + (c - 128)] = (bf16)f2bf(-x62); GNW[63 * 128 + (c - 128)] = (bf16)f2bf(-x63); }
#undef GDN_RHS
#undef GDN_L4
    } else {
        const int t2 = tid - 256; const float gl = gcs[63];
        { const int i = t2 >> 2, d0 = (t2 & 3) * 32; const float e = __expf(gcs[i]);
#pragma unroll
          for (int x8 = 0; x8 < 4; ++x8) { const v4f a = *(const LAS v4f*)(qs + i * QP + d0 + 8 * x8), b = *(const LAS v4f*)(qs + i * QP + d0 + 8 * x8 + 4);
              v4u w; w.x = pk2(a.x * e, a.y * e); w.y = pk2(a.z * e, a.w * e); w.z = pk2(b.x * e, b.y * e); w.w = pk2(b.z * e, b.w * e); *(v4u*)(GQG + i * 128 + d0 + 8 * x8) = w; } }
        { const int d = t2 >> 1, j0 = (t2 & 1) * 32;
#pragma unroll
          for (int x8 = 0; x8 < 4; ++x8) { float o[8];
#pragma unroll
              for (int x = 0; x < 8; ++x) { const int j = j0 + 8 * x8 + x; o[x] = ks[j * QP + d] * __expf(gl - gcs[j]); }
              v4u w; w.x = pk2(o[0], o[1]); w.y = pk2(o[2], o[3]); w.z = pk2(o[4], o[5]); w.w = pk2(o[6], o[7]); *(v4u*)(GKT + d * 64 + j0 + 8 * x8) = w; } }
        if (t2 == 0) GDL[item] = __expf(gl);
    }
    __syncthreads();
}
struct GdnFrags { bf16x8_t nw[4], qg[4], at[2], kt[2][2]; float u[4]; float dl; };
__device__ __forceinline__ void gdn_load(GdnFrags& F, const Params& p, int item, int off128, int off64, int offk, int offu) {
    const bf16* GNW = (const bf16*)(p.ws + WS_GNW) + (size_t)item * 8192; const bf16* GQG = (const bf16*)(p.ws + WS_GQG) + (size_t)item * 8192;
    const bf16* GAT = (const bf16*)(p.ws + WS_GAT) + (size_t)item * 4096; const bf16* GKT = (const bf16*)(p.ws + WS_GKT) + (size_t)item * 8192; const float* GU = (const float*)(p.ws + WS_GU) + (size_t)item * 8192;
#pragma unroll
    for (int ks = 0; ks < 4; ++ks) { F.nw[ks] = *(const bf16x8_t*)(GNW + off128 + 32 * ks); F.qg[ks] = *(const bf16x8_t*)(GQG + off128 + 32 * ks); }
#pragma unroll
    for (int ks = 0; ks < 2; ++ks) { F.at[ks] = *(const bf16x8_t*)(GAT + off64 + 32 * ks); F.kt[0][ks] = *(const bf16x8_t*)(GKT + offk + 32 * ks); F.kt[1][ks] = *(const bf16x8_t*)(GKT + offk + 1024 + 32 * ks); }
#pragma unroll
    for (int r = 0; r < 4; ++r) F.u[r] = GU[offu + r * 128];
    F.dl = ((const float*)(p.ws + WS_GDL))[item];
}
constexpr int STP = 136, VNP = 72;
__device__ __forceinline__ void gdn_seq(const Params& p, LAS unsigned char* lds, int wgi, int wave, int lane) {
    const int u = wgi * 2 + (wave >> 2), wi = wave & 3, h = u >> 3, sl = u & 7, g = lane >> 4, c = lane & 15;
    LAS unsigned short* ST = (LAS unsigned short*)(lds + (wave >> 2) * 12288);
    LAS unsigned short* VNT = ST + 2 * 16 * STP;
    float* GO = (float*)(p.ws + WS_GO);
    const int off128 = (16 * wi + c) * 128 + 8 * g, off64 = (16 * wi + c) * 64 + 8 * g, offk = (32 * wi + c) * 64 + 8 * g, offu = (16 * wi + 4 * g) * 128 + 16 * sl + c;
#pragma unroll
    for (int mt = 0; mt < 2; ++mt) *(LAS v2u*)(ST + c * STP + 16 * (2 * wi + mt) + 4 * g) = (v2u){0u, 0u};
    pg8::f32x4 Sacc[2] = {{0.f, 0.f, 0.f, 0.f}, {0.f, 0.f, 0.f, 0.f}};
    __syncthreads();
    GdnFrags F0, F1;
    gdn_load(F0, p, h, off128, off64, offk, offu);
#define GDN_STEP(F, n_) do { const int cur = (n_) & 1; bf16x8_t sf[4]; \
        _Pragma("unroll") for (int ks = 0; ks < 4; ++ks) sf[ks] = *(const LAS bf16x8_t*)(ST + cur * 16 * STP + c * STP + 32 * ks + 8 * g); \
        pg8::f32x4 vn = {F.u[0], F.u[1], F.u[2], F.u[3]}; \
        _Pragma("unroll") for (int ks = 0; ks < 4; ++ks) vn = __builtin_amdgcn_mfma_f32_16x16x32_bf16(F.nw[ks], sf[ks], vn, 0, 0, 0); \
        { v2u w; w.x = pk2(vn[0], vn[1]); w.y = pk2(vn[2], vn[3]); *(LAS v2u*)(VNT + c * VNP + 16 * wi + 4 * g) = w; } \
        LDS_BAR(); \
        const bf16x8_t v0 = *(const LAS bf16x8_t*)(VNT + c * VNP + 8 * g), v1 = *(const LAS bf16x8_t*)(VNT + c * VNP + 32 + 8 * g); \
        pg8::f32x4 o = {0.f, 0.f, 0.f, 0.f}; \
        _Pragma("unroll") for (int ks = 0; ks < 4; ++ks) o = __builtin_amdgcn_mfma_f32_16x16x32_bf16(F.qg[ks], sf[ks], o, 0, 0, 0); \
        o = __builtin_amdgcn_mfma_f32_16x16x32_bf16(F.at[0], v0, o, 0, 0, 0); o = __builtin_amdgcn_mfma_f32_16x16x32_bf16(F.at[1], v1, o, 0, 0, 0); \
        { const size_t tb = (size_t)(n_) * 64 + 16 * wi + 4 * g; _Pragma("unroll") for (int r = 0; r < 4; ++r) GO[(tb + r) * BW + h * 128 + 16 * sl + c] = o[r]; } \
        _Pragma("unroll") for (int mt = 0; mt < 2; ++mt) { Sacc[mt] = Sacc[mt] * F.dl; \
            Sacc[mt] = __builtin_amdgcn_mfma_f32_16x16x32_bf16(F.kt[mt][0], v0, Sacc[mt], 0, 0, 0); Sacc[mt] = __builtin_amdgcn_mfma_f32_16x16x32_bf16(F.kt[mt][1], v1, Sacc[mt], 0, 0, 0); \
            v2u w; w.x = pk2(Sacc[mt][0], Sacc[mt][1]); w.y = pk2(Sacc[mt][2], Sacc[mt][3]); *(LAS v2u*)(ST + (cur ^ 1) * 16 * STP + c * STP + 16 * (2 * wi + mt) + 4 * g) = w; } \
        LDS_BAR(); } while (0)
    for (int n = 0; n < T / 64; n += 2) {
        gdn_load(F1, p, (n + 1) * 4 + h, off128, off64, offk, offu);
        GDN_STEP(F0, n);
        gdn_load(F0, p, ((n + 2 < T / 64) ? n + 2 : n) * 4 + h, off128, off64, offk, offu);
        GDN_STEP(F1, n + 1);
    }
#undef GDN_STEP
}

constexpr int SEQ_UOFF = 132096;
constexpr int GI_NW = 0, GI_QG = 8704, GI_AT = 17408, GI_KT = 22016, GI_SZ = 31232;
struct GdnStage { v4u r[7]; float u[4]; float dl; };
__device__ __forceinline__ void gdn_stage_load(GdnStage& Sg, const Params& p, int item, int tid, int offu) {
    const bf16* GNW = (const bf16*)(p.ws + WS_GNW) + (size_t)item * 8192; const bf16* GQG = (const bf16*)(p.ws + WS_GQG) + (size_t)item * 8192;
    const bf16* GAT = (const bf16*)(p.ws + WS_GAT) + (size_t)item * 4096; const bf16* GKT = (const bf16*)(p.ws + WS_GKT) + (size_t)item * 8192; const float* GU = (const float*)(p.ws + WS_GU) + (size_t)item * 8192;
    Sg.r[0] = *(const v4u*)(GNW + 8 * tid); Sg.r[1] = *(const v4u*)(GNW + 8 * (tid + 512)); Sg.r[2] = *(const v4u*)(GQG + 8 * tid); Sg.r[3] = *(const v4u*)(GQG + 8 * (tid + 512));
    Sg.r[4] = *(const v4u*)(GAT + 8 * tid); Sg.r[5] = *(const v4u*)(GKT + 8 * tid); Sg.r[6] = *(const v4u*)(GKT + 8 * (tid + 512));
#pragma unroll
    for (int r = 0; r < 4; ++r) Sg.u[r] = GU[offu + r * 128];
    Sg.dl = ((const float*)(p.ws + WS_GDL))[item];
}
__device__ __forceinline__ void gdn_stage_write(const GdnStage& Sg, LAS unsigned short* img, int tid) {
    { const int p0 = tid, p1 = tid + 512;
      *(LAS v4u*)(img + GI_NW + (p0 >> 4) * 136 + 8 * (p0 & 15)) = Sg.r[0]; *(LAS v4u*)(img + GI_NW + (p1 >> 4) * 136 + 8 * (p1 & 15)) = Sg.r[1];
      *(LAS v4u*)(img + GI_QG + (p0 >> 4) * 136 + 8 * (p0 & 15)) = Sg.r[2]; *(LAS v4u*)(img + GI_QG + (p1 >> 4) * 136 + 8 * (p1 & 15)) = Sg.r[3];
      *(LAS v4u*)(img + GI_AT + (p0 >> 3) * 72 + 8 * (p0 & 7)) = Sg.r[4];
      *(LAS v4u*)(img + GI_KT + (p0 >> 3) * 72 + 8 * (p0 & 7)) = Sg.r[5]; *(LAS v4u*)(img + GI_KT + (p1 >> 3) * 72 + 8 * (p1 & 7)) = Sg.r[6]; }
}
__device__ __forceinline__ void gdn_seq2(const Params& p, LAS unsigned char* lds, int wgi, int tid, int wave, int lane) {
    const int h = wgi >> 2, sl = 2 * (wgi & 3) + (wave >> 2), wi = wave & 3, g = lane >> 4, c = lane & 15;
    LAS unsigned short* IMG = (LAS unsigned short*)lds;
    LAS unsigned short* ST = (LAS unsigned short*)(lds + SEQ_UOFF + (wave >> 2) * 12288);
    LAS unsigned short* VNT = ST + 2 * 16 * STP;
    float* GO = (float*)(p.ws + WS_GO);
    const int offu = (16 * wi + 4 * g) * 128 + 16 * sl + c;
#pragma unroll
    for (int mt = 0; mt < 2; ++mt) *(LAS v2u*)(ST + c * STP + 16 * (2 * wi + mt) + 4 * g) = (v2u){0u, 0u};
    pg8::f32x4 Sacc[2] = {{0.f, 0.f, 0.f, 0.f}, {0.f, 0.f, 0.f, 0.f}};
    GdnStage A, B;
    gdn_stage_load(A, p, h, tid, offu); gdn_stage_write(A, IMG, tid);
    gdn_stage_load(B, p, 4 + h, tid, offu);
    LDS_BAR();
    constexpr int NCH = T / 64;
#define GDN_STEP2(X, Y, n_) do { const int cur = (n_) & 1; const LAS unsigned short* im = IMG + cur * GI_SZ; bf16x8_t sf[4]; \
        _Pragma("unroll") for (int ks = 0; ks < 4; ++ks) sf[ks] = *(const LAS bf16x8_t*)(ST + cur * 16 * STP + c * STP + 32 * ks + 8 * g); \
        pg8::f32x4 vn = {X.u[0], X.u[1], X.u[2], X.u[3]}; const float dl = X.dl; \
        _Pragma("unroll") for (int ks = 0; ks < 4; ++ks) vn = __builtin_amdgcn_mfma_f32_16x16x32_bf16(*(const LAS bf16x8_t*)(im + GI_NW + (16 * wi + c) * 136 + 32 * ks + 8 * g), sf[ks], vn, 0, 0, 0); \
        { v2u w; w.x = pk2(vn[0], vn[1]); w.y = pk2(vn[2], vn[3]); *(LAS v2u*)(VNT + c * VNP + 16 * wi + 4 * g) = w; } \
        pg8::f32x4 o = {0.f, 0.f, 0.f, 0.f}; \
        _Pragma("unroll") for (int ks = 0; ks < 4; ++ks) o = __builtin_amdgcn_mfma_f32_16x16x32_bf16(*(const LAS bf16x8_t*)(im + GI_QG + (16 * wi + c) * 136 + 32 * ks + 8 * g), sf[ks], o, 0, 0, 0); \
        LDS_BAR(); \
        gdn_stage_load(X, p, (((n_) + 2 < NCH) ? (n_) + 2 : (n_)) * 4 + h, tid, offu); \
        const bf16x8_t v0 = *(const LAS bf16x8_t*)(VNT + c * VNP + 8 * g), v1 = *(const LAS bf16x8_t*)(VNT + c * VNP + 32 + 8 * g); \
        o = __builtin_amdgcn_mfma_f32_16x16x32_bf16(*(const LAS bf16x8_t*)(im + GI_AT + (16 * wi + c) * 72 + 8 * g), v0, o, 0, 0, 0); \
        o = __builtin_amdgcn_mfma_f32_16x16x32_bf16(*(const LAS bf16x8_t*)(im + GI_AT + (16 * wi + c) * 72 + 32 + 8 * g), v1, o, 0, 0, 0); \
        { const size_t tb = (size_t)(n_) * 64 + 16 * wi + 4 * g; _Pragma("unroll") for (int r = 0; r < 4; ++r) GO[(tb + r) * BW + h * 128 + 16 * sl + c] = o[r]; } \
        _Pragma("unroll") for (int mt = 0; mt < 2; ++mt) { Sacc[mt] = Sacc[mt] * dl; \
            Sacc[mt] = __builtin_amdgcn_mfma_f32_16x16x32_bf16(*(const LAS bf16x8_t*)(im + GI_KT + (16 * (2 * wi + mt) + c) * 72 + 8 * g), v0, Sacc[mt], 0, 0, 0); \
            Sacc[mt] = __builtin_amdgcn_mfma_f32_16x16x32_bf16(*(const LAS bf16x8_t*)(im + GI_KT + (16 * (2 * wi + mt) + c) * 72 + 32 + 8 * g), v1, Sacc[mt], 0, 0, 0); \
            v2u w; w.x = pk2(Sacc[mt][0], Sacc[mt][1]); w.y = pk2(Sacc[mt][2], Sacc[mt][3]); *(LAS v2u*)(ST + (cur ^ 1) * 16 * STP + c * STP + 16 * (2 * wi + mt) + 4 * g) = w; } \
        gdn_stage_write(Y, IMG + (cur ^ 1) * GI_SZ, tid); \
        LDS_BAR(); } while (0)
    for (int n = 0; n < NCH; n += 2) { GDN_STEP2(A, B, n); GDN_STEP2(B, A, n + 1); }
#undef GDN_STEP2
}
constexpr int MI_Q = 0, MI_S = 4608, MI_K = 9216, MI_SZ = 13824;
struct MlStage { v4u r[3]; bf16x8_t vt[2]; float fl; };
__device__ __forceinline__ void ml_stage_load(MlStage& Sg, const Params& p, int item, int tid, int offV) {
    const bf16* MQ = (const bf16*)(p.ws + WS_MQ) + (size_t)item * 4096; const bf16* MS = (const bf16*)(p.ws + WS_MS) + (size_t)item * 4096; const bf16* MK = (const bf16*)(p.ws + WS_MK) + (size_t)item * 4096;
    const bf16* MV = (const bf16*)(p.ws + WS_MV) + (size_t)item * 9216;
    Sg.r[0] = *(const v4u*)(MQ + 8 * tid); Sg.r[1] = *(const v4u*)(MS + 8 * tid); Sg.r[2] = *(const v4u*)(MK + 8 * tid);
    Sg.vt[0] = *(const bf16x8_t*)(MV + offV); Sg.vt[1] = *(const bf16x8_t*)(MV + offV + 32);
    Sg.fl = ((const float*)(p.ws + WS_MFL))[item];
}
__device__ __forceinline__ void ml_stage_write(const MlStage& Sg, LAS unsigned short* img, int tid) {
    const int o = (tid >> 3) * 72 + 8 * (tid & 7);
    *(LAS v4u*)(img + MI_Q + o) = Sg.r[0]; *(LAS v4u*)(img + MI_S + o) = Sg.r[1]; *(LAS v4u*)(img + MI_K + o) = Sg.r[2];
}
__device__ __forceinline__ void ml_seq2(const Params& p, LAS unsigned char* lds, int wgi, int tid, int wave, int lane) {
    const int h = wgi / 5, sl0 = 2 * (wgi % 5) + (wave >> 2), wi = wave & 3, g = lane >> 4, c = lane & 15;
    const bool real = sl0 < 9; const int sl = real ? sl0 : 8;
    LAS unsigned short* IMG = (LAS unsigned short*)lds;
    LAS unsigned short* CT = (LAS unsigned short*)(lds + SEQ_UOFF + (wave >> 2) * 8192);
    float* HO = (float*)(p.ws + WS_HO); float* HDEN = (float*)(p.ws + WS_HDEN);
    const int offV = (16 * sl + c) * 64 + 8 * g;
    *(LAS v2u*)(CT + c * 72 + 16 * wi + 4 * g) = (v2u){0u, 0u};
    pg8::f32x4 Cacc = {0.f, 0.f, 0.f, 0.f};
    MlStage A, B;
    ml_stage_load(A, p, h, tid, offV); ml_stage_write(A, IMG, tid);
    ml_stage_load(B, p, 4 + h, tid, offV);
    LDS_BAR();
    constexpr int NCH = T / 64;
#define ML_STEP2(X, Y, n_) do { const int cur = (n_) & 1; const LAS unsigned short* im = IMG + cur * MI_SZ; const int ro = (16 * wi + c) * 72 + 8 * g; \
        const bf16x8_t c0 = *(const LAS bf16x8_t*)(CT + cur * 16 * 72 + c * 72 + 8 * g), c1 = *(const LAS bf16x8_t*)(CT + cur * 16 * 72 + c * 72 + 32 + 8 * g); \
        const bf16x8_t vt0 = X.vt[0], vt1 = X.vt[1]; const float fl = X.fl; \
        pg8::f32x4 num = {0.f, 0.f, 0.f, 0.f}; \
        num = __builtin_amdgcn_mfma_f32_16x16x32_bf16(*(const LAS bf16x8_t*)(im + MI_Q + ro), c0, num, 0, 0, 0); num = __builtin_amdgcn_mfma_f32_16x16x32_bf16(*(const LAS bf16x8_t*)(im + MI_Q + ro + 32), c1, num, 0, 0, 0); \
        num = __builtin_amdgcn_mfma_f32_16x16x32_bf16(*(const LAS bf16x8_t*)(im + MI_S + ro), vt0, num, 0, 0, 0); num = __builtin_amdgcn_mfma_f32_16x16x32_bf16(*(const LAS bf16x8_t*)(im + MI_S + ro + 32), vt1, num, 0, 0, 0); \
        Cacc = Cacc * fl; \
        Cacc = __builtin_amdgcn_mfma_f32_16x16x32_bf16(*(const LAS bf16x8_t*)(im + MI_K + ro), vt0, Cacc, 0, 0, 0); Cacc = __builtin_amdgcn_mfma_f32_16x16x32_bf16(*(const LAS bf16x8_t*)(im + MI_K + ro + 32), vt1, Cacc, 0, 0, 0); \
        ml_stage_load(X, p, (((n_) + 2 < NCH) ? (n_) + 2 : (n_)) * 4 + h, tid, offV); \
        { v2u w; w.x = pk2(Cacc[0], Cacc[1]); w.y = pk2(Cacc[2], Cacc[3]); *(LAS v2u*)(CT + (cur ^ 1) * 16 * 72 + c * 72 + 16 * wi + 4 * g) = w; } \
        { const size_t tb = (size_t)(n_) * 64 + 16 * wi + 4 * g; \
          if (sl < 8) { _Pragma("unroll") for (int r = 0; r < 4; ++r) HO[(tb + r) * BW + h * 128 + 16 * sl + c] = num[r]; } \
          else if (c == 0 && real) { _Pragma("unroll") for (int r = 0; r < 4; ++r) HDEN[(tb + r) * 4 + h] = num[r]; } } \
        ml_stage_write(Y, IMG + (cur ^ 1) * MI_SZ, tid); \
        LDS_BAR(); } while (0)
    for (int n = 0; n < NCH; n += 2) { ML_STEP2(A, B, n); ML_STEP2(B, A, n + 1); }
#undef ML_STEP2
}

__device__ __forceinline__ void mixer_gmlp_item(const Params& p, int l, LAS unsigned char* lds, int item, int tid, int wave, int lane) {
    const int chunk = item >> 2, g = item & 3; const size_t tok0 = (size_t)chunk * 128;
    const bf16* Z = (const bf16*)(p.ws + WS_Z); bf16* BR1 = (bf16*)(p.ws + WS_BR) + (size_t)1 * T * BW;
    const float* ng = p.in[I_GMNG] + l * BW; const float* nb = p.in[I_GMNB] + l * BW;
    const float* wsp = p.in[I_GMWS] + ((size_t)(l * 4 + g) * 128) * 128; const float* bsp = p.in[I_GMBS] + (l * 4 + g) * 128;
    LAS float* vn = (LAS float*)lds;
    for (int r = 0; r < 16; ++r) { const int tk = wave * 16 + r;
        const v4u raw = *(const v4u*)(Z + (tok0 + tk) * ZC + ZC_GMV + 8 * lane); float x[8]; unpack8(raw, x); float s = 0.f;
#pragma unroll
        for (int i = 0; i < 8; ++i) { x[i] = gelu_tanh(x[i]); s += x[i]; }
        const float mean = wave_sum(s) * (1.f / 512.f); float ss = 0.f;
#pragma unroll
        for (int i = 0; i < 8; ++i) { x[i] -= mean; ss += x[i] * x[i]; }
        const float rstd = rsqrtf(wave_sum(ss) * (1.f / 512.f) + LN_EPS);
        if ((lane >> 4) == g) { const int cl = 8 * (lane & 15);
#pragma unroll
            for (int i = 0; i < 8; ++i) vn[tk * 128 + cl + i] = x[i] * rstd * ng[8 * lane + i] + nb[8 * lane + i]; }
    }
    __syncthreads();
    const int t = tid >> 2, cq = tid & 3; float acc[32];
#pragma unroll
    for (int i = 0; i < 32; ++i) acc[i] = 0.f;
    const float* wrow = wsp + (size_t)t * 128;
    for (int s = 0; s <= t; ++s) { const float w = wrow[s]; const LAS float* row = vn + s * 128 + cq * 32;
#pragma unroll
        for (int i4 = 0; i4 < 8; ++i4) { const v4f a = *(const LAS v4f*)(row + 4 * i4); acc[4 * i4] += w * a.x; acc[4 * i4 + 1] += w * a.y; acc[4 * i4 + 2] += w * a.z; acc[4 * i4 + 3] += w * a.w; } }
    const float bias = bsp[t];
#pragma unroll
    for (int i8 = 0; i8 < 4; ++i8) { const v4u raw = *(const v4u*)(Z + (tok0 + t) * ZC + ZC_GMU + g * 128 + cq * 32 + 8 * i8); float u[8]; unpack8(raw, u); float o[8];
#pragma unroll
        for (int i = 0; i < 8; ++i) o[i] = gelu_tanh(u[i]) * (acc[8 * i8 + i] + bias);
        v4u w; w.x = pk2(o[0], o[1]); w.y = pk2(o[2], o[3]); w.z = pk2(o[4], o[5]); w.w = pk2(o[6], o[7]);
        *(v4u*)(BR1 + (tok0 + t) * BW + g * 128 + cq * 32 + 8 * i8) = w; }
    __syncthreads();
}

__device__ __forceinline__ void vt_item(const Params& p, LAS unsigned char* lds, int item, int tid) {
    const int h = item & 3, n = item >> 2; const size_t t0 = (size_t)n * 64;
    const bf16* Z = (const bf16*)(p.ws + WS_Z); bf16* VT = (bf16*)(p.ws + WS_VT);
    LAS unsigned short* vs = (LAS unsigned short*)lds;
#pragma unroll
    for (int r = 0; r < 2; ++r) { const int idx = tid + 512 * r, tk = idx >> 4, c8 = idx & 15;
        *(LAS v4u*)(vs + tk * 136 + 8 * c8) = *(const v4u*)(Z + (t0 + tk) * ZC + ZC_SBV + h * 128 + 8 * c8); }
    __syncthreads();
    { const int d = tid >> 2, jq = tid & 3; unsigned w[8];
#pragma unroll
      for (int x = 0; x < 8; ++x) w[x] = (unsigned)vs[(16 * jq + 2 * x) * 136 + d] | ((unsigned)vs[(16 * jq + 2 * x + 1) * 136 + d] << 16);
      bf16* dst = VT + ((size_t)h * 128 + d) * T + t0 + 16 * jq;
      *(v4u*)dst = (v4u){w[0], w[1], w[2], w[3]}; *(v4u*)(dst + 8) = (v4u){w[4], w[5], w[6], w[7]}; }
    __syncthreads();
}
constexpr int KTP = 136, VTP = 72;
__device__ __forceinline__ void sb_unit(const Params& p, LAS unsigned char* lds, int unit, int tid, int wave, int lane) {
    const int h = unit >> 6, q0 = (unit & 63) * 128, g = lane >> 4, c = lane & 15; const int qrow = q0 + 16 * wave + c;
    const bf16* Z = (const bf16*)(p.ws + WS_Z); const bf16* VT = (const bf16*)(p.ws + WS_VT) + (size_t)h * 128 * T; bf16* BR0 = (bf16*)(p.ws + WS_BR);
    LAS unsigned short* Kt = (LAS unsigned short*)lds;
    LAS unsigned short* Vt = Kt + 2 * 64 * KTP;
    LAS int* flags = (LAS int*)(Vt + 2 * 128 * VTP);
    bf16x8_t qf[4];
#pragma unroll
    for (int ks = 0; ks < 4; ++ks) qf[ks] = *(const bf16x8_t*)(Z + (size_t)qrow * ZC + ZC_SBQ + h * 128 + 32 * ks + 8 * g);
    pg8::f32x4 acc[8];
#pragma unroll
    for (int dt = 0; dt < 8; ++dt) acc[dt] = (pg8::f32x4){0.f, 0.f, 0.f, 0.f};
    float racc = 0.f;
    v4u kr[2], vr[2];
    const int jt = (q0 >> 6) + 1;
#define SB_GLOAD(j_) do { _Pragma("unroll") for (int r = 0; r < 2; ++r) { const int idx = tid + 512 * r; \
        kr[r] = *(const v4u*)(Z + (size_t)(64 * (j_) + (idx >> 4)) * ZC + ZC_SBK + h * 128 + 8 * (idx & 15)); \
        vr[r] = *(const v4u*)(VT + (size_t)(idx >> 3) * T + 64 * (j_) + 8 * (idx & 7)); } } while (0)
#define SB_LWRITE(b_) do { _Pragma("unroll") for (int r = 0; r < 2; ++r) { const int idx = tid + 512 * r; \
        *(LAS v4u*)(Kt + (b_) * 64 * KTP + (idx >> 4) * KTP + 8 * (idx & 15)) = kr[r]; *(LAS v4u*)(Vt + (b_) * 128 * VTP + (idx >> 3) * VTP + 8 * (idx & 7)) = vr[r]; } } while (0)
    LDS_BAR();
    SB_GLOAD(jt); SB_LWRITE(0);
    LDS_BAR();
    for (int j = jt, it = 0; j >= 0; --j, ++it) {
        const int cur = it & 1;
        SB_GLOAD(j > 0 ? j - 1 : 0);
        const bool wdone = __all(racc > 104.f);
        if (64 * j < q0 + 16 * wave + 15 && !wdone) {
            const LAS unsigned short* Kc = Kt + cur * 64 * KTP; const LAS unsigned short* Vc = Vt + cur * 128 * VTP;
            pg8::f32x4 z[4];
#pragma unroll
            for (int s = 0; s < 4; ++s) { z[s] = (pg8::f32x4){0.f, 0.f, 0.f, 0.f};
#pragma unroll
                for (int ks = 0; ks < 4; ++ks) z[s] = __builtin_amdgcn_mfma_f32_16x16x32_bf16(*(const LAS bf16x8_t*)(Kc + (16 * s + c) * KTP + 32 * ks + 8 * g), qf[ks], z[s], 0, 0, 0); }
            float sp[4][4], t[4], xs[4]; bool mk[4][4];
#pragma unroll
            for (int s = 0; s < 4; ++s) { t[s] = 0.f;
#pragma unroll
                for (int r = 0; r < 4; ++r) { const int key = 64 * j + 16 * s + 4 * g + r; mk[s][r] = key < qrow; const float zz = z[s][r] * 0.08838834764831845f; z[s][r] = zz;
                    sp[s][r] = mk[s][r] ? softplusf_(zz) : 0.f; t[s] += sp[s][r]; } }
            float grand = 0.f, higher[4];
#pragma unroll
            for (int s = 3; s >= 0; --s) { float x = t[s]; float y = __shfl(x, lane + 16); x += (g < 3) ? y : 0.f; y = __shfl(x, lane + 32); x += (g < 2) ? y : 0.f;
                xs[s] = x - t[s];
                const float tot = __shfl(x, c); higher[s] = grand; grand += tot; }
            bf16x8_t pf[2];
#pragma unroll
            for (int s = 0; s < 4; ++s) { float a[4]; float e = 0.f;
#pragma unroll
                for (int r = 3; r >= 0; --r) { const float la = z[s][r] - sp[s][r] - (racc + higher[s] + xs[s] + e); a[r] = mk[s][r] ? __expf(la) : 0.f; e += sp[s][r]; }
                const unsigned w0 = pk2(a[0], a[1]), w1 = pk2(a[2], a[3]);
                if ((s & 1) == 0) { pf[s >> 1][0] = (short)(w0 & 0xffff); pf[s >> 1][1] = (short)(w0 >> 16); pf[s >> 1][2] = (short)(w1 & 0xffff); pf[s >> 1][3] = (short)(w1 >> 16); }
                else              { pf[s >> 1][4] = (short)(w0 & 0xffff); pf[s >> 1][5] = (short)(w0 >> 16); pf[s >> 1][6] = (short)(w1 & 0xffff); pf[s >> 1][7] = (short)(w1 >> 16); } }
            racc += grand;
#pragma unroll
            for (int dt = 0; dt < 8; ++dt)
#pragma unroll
                for (int k2 = 0; k2 < 2; ++k2) { const v2u lo = *(const LAS v2u*)(Vc + (16 * dt + c) * VTP + 32 * k2 + 4 * g), hi = *(const LAS v2u*)(Vc + (16 * dt + c) * VTP + 32 * k2 + 16 + 4 * g);
                    const v4u vv = (v4u){lo.x, lo.y, hi.x, hi.y};
                    acc[dt] = __builtin_amdgcn_mfma_f32_16x16x32_bf16(__builtin_bit_cast(bf16x8_t, vv), pf[k2], acc[dt], 0, 0, 0); }
        }
        const bool wd2 = __all(racc > 104.f);
        if (lane == 0) flags[cur * 8 + wave] = wd2 ? 1 : 0;
        SB_LWRITE(cur ^ 1);
        LDS_BAR();
        int alld = 1;
#pragma unroll
        for (int w = 0; w < 8; ++w) alld &= flags[cur * 8 + w];
        if (alld) break;
    }
#undef SB_GLOAD
#undef SB_LWRITE
#pragma unroll
    for (int dt = 0; dt < 8; ++dt) { v2u w; w.x = pk2(acc[dt][0], acc[dt][1]); w.y = pk2(acc[dt][2], acc[dt][3]); *(v2u*)(BR0 + (size_t)qrow * BW + h * 128 + 16 * dt + 4 * g) = w; }
}

__device__ __forceinline__ void phase_mixers(const Params& p, int l, LAS unsigned char* lds, int wg, int G, int tid, int wave, int lane, const XcdBarrier& bar) {
#if defined(PROBE_SPLIT)
    if (wg < 16) gdn_seq2(p, lds, wg, tid, wave, lane); else if (wg < 36) ml_seq2(p, lds, wg - 16, tid, wave, lane);
    xcd_barrier(bar);
    const int w2 = wg, G2 = G;
#else
    if (wg < 16) { gdn_seq2(p, lds, wg, tid, wave, lane); return; }
    if (wg < 36) { ml_seq2(p, lds, wg - 16, tid, wave, lane); return; }
    const int w2 = wg - 36, G2 = G - 36;
#endif
    for (int it = w2; it < 256; it += G2) mixer_gmlp_item(p, l, lds, it, tid, wave, lane);
    for (int it = w2; it < 256; it += G2) sb_unit(p, lds, it, tid, wave, lane);
    __syncthreads();
    phase_convert<1>(p, l, lds, w2 * 8 + wave, G2 * 8, wave, lane);
}

__device__ __forceinline__ void phase_post(const Params& p, int l, int gw, int NGW, int lane) {
    const bf16* Z = (const bf16*)(p.ws + WS_Z); const float* GO = (const float*)(p.ws + WS_GO); const float* HO = (const float*)(p.ws + WS_HO); const float* HDEN = (const float*)(p.ws + WS_HDEN);
    bf16* BR2 = (bf16*)(p.ws + WS_BR) + (size_t)2 * T * BW; bf16* BR3 = (bf16*)(p.ws + WS_BR) + (size_t)3 * T * BW;
    const float* gng = p.in[I_GDNNG] + l * 128; const float* mng = p.in[I_MLNG] + l * BW;
    for (int t = gw; t < T; t += NGW) {
        {   const v4f a0 = *(const v4f*)(GO + (size_t)t * BW + 8 * lane), a1 = *(const v4f*)(GO + (size_t)t * BW + 8 * lane + 4); float o[8] = {a0.x, a0.y, a0.z, a0.w, a1.x, a1.y, a1.z, a1.w}; float ss = 0.f;
#pragma unroll
            for (int i = 0; i < 8; ++i) ss += o[i] * o[i];
            const float r = rsqrtf(sum16(ss) * (1.f / 128.f) + LN_EPS);
            const v4u graw = *(const v4u*)(Z + (size_t)t * ZC + ZC_GDNG + 8 * lane); float gt[8]; unpack8(graw, gt);
#pragma unroll
            for (int i = 0; i < 8; ++i) o[i] = o[i] * r * gng[(8 * lane + i) & 127] * siluf_(gt[i]);
            v4u w; w.x = pk2(o[0], o[1]); w.y = pk2(o[2], o[3]); w.z = pk2(o[4], o[5]); w.w = pk2(o[6], o[7]); *(v4u*)(BR2 + (size_t)t * BW + 8 * lane) = w; }
        {   const v4f a0 = *(const v4f*)(HO + (size_t)t * BW + 8 * lane), a1 = *(const v4f*)(HO + (size_t)t * BW + 8 * lane + 4); float o[8] = {a0.x, a0.y, a0.z, a0.w, a1.x, a1.y, a1.z, a1.w}; float ss = 0.f;
            const float dn = 1.f / fmaxf(fabsf(HDEN[(size_t)t * 4 + (lane >> 4)]), 1.f);
#pragma unroll
            for (int i = 0; i < 8; ++i) { o[i] *= dn; ss += o[i] * o[i]; }
            const float r = rsqrtf(sum16(ss) * (1.f / 128.f) + LN_EPS);
            const v4u graw = *(const v4u*)(Z + (size_t)t * ZC + ZC_MLO + 8 * lane); float gt[8]; unpack8(graw, gt);
#pragma unroll
            for (int i = 0; i < 8; ++i) o[i] = o[i] * r * mng[8 * lane + i] * sigmoidf_(gt[i]);
            v4u w; w.x = pk2(o[0], o[1]); w.y = pk2(o[2], o[3]); w.z = pk2(o[4], o[5]); w.w = pk2(o[6], o[7]); *(v4u*)(BR3 + (size_t)t * BW + 8 * lane) = w; }
    }
}

__device__ __forceinline__ void ln_row(const float* yrow, const float* g, const float* b, int lane, v4f (&v)[8]) {
    const v4f* yr = (const v4f*)yrow + lane; float s = 0.f;
#pragma unroll
    for (int j = 0; j < 8; ++j) { v[j] = yr[64 * j]; s += (v[j].x + v[j].y) + (v[j].z + v[j].w); }
    const float mean = wave_sum(s) * (1.f / D); float s2 = 0.f;
#pragma unroll
    for (int j = 0; j < 8; ++j) { v[j] = v[j] - mean; s2 += (v[j].x * v[j].x + v[j].y * v[j].y) + (v[j].z * v[j].z + v[j].w * v[j].w); }
    const float rstd = rsqrtf(wave_sum(s2) * (1.f / D) + LN_EPS);
#pragma unroll
    for (int j = 0; j < 8; ++j) { const v4f gg = ((const v4f*)g)[lane + 64 * j], bb = ((const v4f*)b)[lane + 64 * j]; v[j] = v[j] * rstd * gg + bb; }
}
__device__ __forceinline__ void phase_ln1_router(const Params& p, int l, LAS unsigned char* lds, int wg, int G, int wave, int lane, int cnt_shift = 0) {
    const float* Y = (const float*)(p.ws + WS_Y); float* X1 = (float*)(p.ws + WS_X1); bf16* X1B = (bf16*)(p.ws + WS_X1B); int* LIST = (int*)(p.ws + WS_LIST); float* WL = (float*)(p.ws + WS_WL); unsigned* SLOT = (unsigned*)(p.ws + WS_SLOT);
    unsigned* cnt = (unsigned*)(p.ws + WS_CTL) + CW_CNT + l * 4096 + cnt_shift;
    const float* g1 = p.in[I_LN1G] + (size_t)l * D; const float* b1 = p.in[I_LN1B] + (size_t)l * D;
    const float* wr = p.in[I_WR] + (size_t)l * D * NE; const float rbias = p.in[I_RB][l * NE + lane];
    LAS float* xt = (LAS float*)lds;
    LAS float* part = (LAS float*)(lds + 65536);
    LAS unsigned* selm = (LAS unsigned*)(lds + 65536 + 16384);
    LAS float* wtm = (LAS float*)(lds + 65536 + 16384 + 16640);
    LAS unsigned char* rkm = (LAS unsigned char*)(lds + 65536 + 16384 + 16640 + 16384);
    for (int tl = wg; tl < T / 8; tl += G) {
        const size_t m = (size_t)tl * 8 + wave;
        {   v4f v[8]; ln_row(Y + m * D, g1, b1, lane, v);
            v4f* xo = (v4f*)(X1 + m * D) + lane; v2u* xb = (v2u*)(X1B + m * D) + lane;
#pragma unroll
            for (int j = 0; j < 8; ++j) { xo[64 * j] = v[j]; v2u o; o.x = pk2(v[j].x, v[j].y); o.y = pk2(v[j].z, v[j].w); xb[64 * j] = o; *(LAS v4f*)(xt + wave * D + 4 * lane + 256 * j) = v[j]; } }
        __syncthreads();
        {   float acc[8];
#pragma unroll
            for (int r = 0; r < 8; ++r) acc[r] = 0.f;
#pragma unroll 2
            for (int d4 = 0; d4 < 64; ++d4) { const int d = wave * 256 + 4 * d4;
                const float w0 = wr[(size_t)(d + 0) * NE + lane], w1 = wr[(size_t)(d + 1) * NE + lane], w2 = wr[(size_t)(d + 2) * NE + lane], w3 = wr[(size_t)(d + 3) * NE + lane];
#pragma unroll
                for (int r = 0; r < 8; ++r) { const v4f xv = *(const LAS v4f*)(xt + r * D + d); acc[r] += xv.x * w0 + xv.y * w1 + xv.z * w2 + xv.w * w3; } }
#pragma unroll
            for (int r = 0; r < 8; ++r) part[(wave * 8 + r) * 64 + lane] = acc[r]; }
        __syncthreads();
        {   float logit = 0.f;
#pragma unroll
            for (int w = 0; w < 8; ++w) logit += part[(w * 8 + wave) * 64 + lane];
            const float s = sigmoidf_(logit), biased = s + rbias;
            const float m1 = max8(biased); const float li = (float)(lane & 7);
            const float first = min8(biased == m1 ? li : 8.f);
            const float m2 = max8(li == first ? -INFINITY : biased);
            const float gs = m1 + m2; const int myg = lane >> 3; int grank = 0;
#pragma unroll
            for (int g2 = 0; g2 < 8; ++g2) { const float o = __builtin_bit_cast(float, __builtin_amdgcn_readlane(__builtin_bit_cast(int, gs), g2 * 8)); grank += (o > gs || (o == gs && g2 < myg)) ? 1 : 0; }
            const float masked = grank < 4 ? biased : -INFINITY; int rank = 0;
#pragma unroll
            for (int e2 = 0; e2 < 64; ++e2) { const float o = __builtin_bit_cast(float, __builtin_amdgcn_readlane(__builtin_bit_cast(int, masked), e2)); rank += (o > masked || (o == masked && e2 < lane)) ? 1 : 0; }
            const float wsel = rank < 6 ? s : 0.f; const float tot = wave_sum(wsel);
            const int ri = ((tl - wg) / G) * 8 + wave;
            selm[ri * 64 + lane] = (rank < 6) ? 1u : 0u; rkm[ri * 64 + lane] = (unsigned char)rank; wtm[ri * 64 + lane] = wsel / tot * 2.5f; }
        __syncthreads();
    }
    const int nrows = ((T / 8 - wg + G - 1) / G) * 8;
    if (wave == 0) { unsigned n = 0;
        for (int r = 0; r < nrows; ++r) n += selm[r * 64 + lane];
        unsigned base = 0; if (n) base = __hip_atomic_fetch_add(cnt + 64 * lane, n, __ATOMIC_RELAXED, __HIP_MEMORY_SCOPE_AGENT);
        selm[64 * 64 + lane] = base; }
    __syncthreads();
    for (int ri = wave; ri < nrows; ri += 8) { unsigned pos = selm[64 * 64 + lane];
        for (int r = 0; r < ri; ++r) pos += selm[r * 64 + lane];
        if (selm[ri * 64 + lane]) { const size_t m = (size_t)(wg + (ri >> 3) * G) * 8 + (ri & 7); const int rk = rkm[ri * 64 + lane];
            LIST[lane * T + pos] = (int)m; WL[lane * T + pos] = wtm[ri * 64 + lane]; SLOT[m * 8 + rk] = ((unsigned)lane << 16) | pos; } }
    __syncthreads();
}
__device__ __forceinline__ void phase_combine_ln2(const Params& p, int l, float* dst, int gw, int NGW, int lane) {
    const float* X1 = (const float*)(p.ws + WS_X1); const bf16* YE = (const bf16*)(p.ws + WS_YEXP); const unsigned* SLOT = (const unsigned*)(p.ws + WS_SLOT);
    const unsigned* cnt = (const unsigned*)(p.ws + WS_CTL) + CW_CNT + l * 4096;
    const float* g2 = p.in[I_LN2G] + (size_t)l * D; const float* b2 = p.in[I_LN2B] + (size_t)l * D;
    const int tiles = ((int)cnt[64 * lane] + 255) >> 8; const float incl = wave_scan_incl((float)tiles);
    const int toff = (int)incl - tiles;
    const int tsh = __builtin_amdgcn_readlane((int)incl, 63);
    for (int m = gw; m < T; m += NGW) {
        v4f v[8]; const v4f* xr = (const v4f*)(X1 + (size_t)m * D) + lane;
#pragma unroll
        for (int j = 0; j < 8; ++j) v[j] = xr[64 * j] * ALPHA;
#pragma unroll
        for (int k = 0; k < 7; ++k) { size_t row;
            if (k == 0) row = (size_t)tsh * 256 + m;
            else { const unsigned s = __builtin_amdgcn_readfirstlane(SLOT[(size_t)m * 8 + (k - 1)]); const int e = (int)(s >> 16); row = (size_t)__builtin_amdgcn_readlane(toff, e) * 256 + (s & 0xffffu); }
            const v2u* yr = (const v2u*)(YE + row * D) + lane;
#pragma unroll
            for (int j = 0; j < 8; ++j) { const v2u y = yr[64 * j]; v[j].x += bflo(y.x); v[j].y += bfhi(y.x); v[j].z += bflo(y.y); v[j].w += bfhi(y.y); } }
        float s = 0.f;
#pragma unroll
        for (int j = 0; j < 8; ++j) s += (v[j].x + v[j].y) + (v[j].z + v[j].w);
        const float mean = wave_sum(s) * (1.f / D); float s2 = 0.f;
#pragma unroll
        for (int j = 0; j < 8; ++j) { v[j] = v[j] - mean; s2 += (v[j].x * v[j].x + v[j].y * v[j].y) + (v[j].z * v[j].z + v[j].w * v[j].w); }
        const float rstd = rsqrtf(wave_sum(s2) * (1.f / D) + LN_EPS);
        v4f* xo = (v4f*)(dst + (size_t)m * D) + lane;
#pragma unroll
        for (int j = 0; j < 8; ++j) { const v4f gg = ((const v4f*)g2)[lane + 64 * j], bb = ((const v4f*)b2)[lane + 64 * j]; xo[64 * j] = v[j] * rstd * gg + bb; }
    }
}

constexpr int NPH = 11;
template <class S> struct DupOrder {
    S s; int n;
    __device__ __forceinline__ bool next(int i, Unit& u) const { return s.next(i >= n ? i - n : i, u); }
    __device__ __forceinline__ int row_token(int i, int r) const { return s.row_token(i >= n ? i - n : i, r); }
    __device__ __forceinline__ void a_ready(const Unit& u) const { s.a_ready(u); }
    __device__ __forceinline__ void done(const Unit& u) const { s.done(u); }
};
template <class S> __device__ __forceinline__ int count_units(const S& s) { Unit u; int n = 0; while (n < 64 && s.next(n, u)) ++n; return n; }
#define ORDER_T(k, T) typename std::conditional<PROBE_DUP == (k), DupOrder<T>, T>::type
template <class S> __device__ __forceinline__ DupOrder<S> make_order(const S& s, std::true_type) { DupOrder<S> d{s, count_units(s)}; d.n = count_units(s); return d; }
template <class S> __device__ __forceinline__ S make_order(const S& s, std::false_type) { return s; }
#define MAKE_ORDER(k, s) make_order(s, std::integral_constant<bool, PROBE_DUP == (k)>())
template <int l>
__device__ __forceinline__ void run_layer(const Params& p, LAS unsigned char* lds, const XcdBarrier& bar, int tid, int lane, int wave, int G, int wg, int gw, int NGW) {
    unsigned char* ws = p.ws;
    {
        const float* xin = (l == 0) ? p.in[I_X] : (const float*)(ws + WS_XCUR);
        float* xout = (l == NL - 1) ? p.out : (float*)(ws + WS_XCUR);
#ifndef PROBE_DUP
#define PROBE_DUP (-1)
#endif
#define IS_GEMM_PH(k) ((k) == 1 || (k) == 5 || (k) == 6 || (k) == 8 || (k) == 9)
#define REP(k) _Pragma("nounroll") for (int _r = 0; _r < ((PROBE_DUP == (k) && !IS_GEMM_PH(k)) ? 2 + (p.ph_lo >> 20) : 1); ++_r)
#ifndef PH_MASK
#define PH_MASK 0x7ff
#endif
#define RUN(k) (((PH_MASK >> (k)) & 1) && p.ph_lo <= l * NPH + (k) && l * NPH + (k) < p.ph_hi)
#define SEAM(k) do { if (l * NPH + (k) + 1 < p.ph_hi) xcd_barrier(bar); } while (0)
        if (RUN(0)) { REP(0) { phase_convert<0>(p, l, lds, gw, NGW, wave, lane); phase_xprep(p, l, xin, lds, gw, NGW, tid, lane); } SEAM(0); }
        if (RUN(1)) { REP(1) { pg8::Gemm g{(const bf16*)(ws + WS_XB), (const bf16*)(ws + WS_WIN), T, ZC, D, D, D}; pg8::StaticOrder S; S.init(T, ZC, G, wg);
            pg8::EpiBf16<0> E{(bf16*)(ws + WS_Z), ZC, nullptr, 0, 0, 1.f};
            auto S2 = MAKE_ORDER(1, S); pg8::gemm_phase<pg8::EpiBf16<0>, ORDER_T(1, pg8::StaticOrder), true, true>(lds, g, S2, E); } SEAM(1); }
        if (RUN(2)) { REP(2) { for (int it = wg; it < 1536; it += G) { if (it < 512) gdn_pre_item(p, l, lds, it, tid, wave, lane); else if (it < 1024) ml_pre_item(p, l, lds, it - 512, tid, wave, lane); else vt_item(p, lds, it - 1024, tid); } } SEAM(2); }
        if (RUN(3)) { REP(3) { phase_mixers(p, l, lds, wg, G, tid, wave, lane, bar); } SEAM(3); }
        if (RUN(4)) { REP(4) { phase_post(p, l, gw, NGW, lane); } SEAM(4); }
        if (RUN(5)) { REP(5) { pg8::Gemm g{(const bf16*)(ws + WS_BR), (const bf16*)(ws + WS_WBR), 4 * T, 4 * D, BW, BW, BW}; MergeOrder S{G, wg};
            EpiMerge E{(const bf16*)(ws + WS_Z), (float*)(ws + WS_MTMP), (bf16*)(ws + WS_MSUM)};
            auto S2 = MAKE_ORDER(5, S); pg8::gemm_phase<EpiMerge, ORDER_T(5, MergeOrder), true, true>(lds, g, S2, E); } SEAM(5); }
        if (RUN(6)) { REP(6) { pg8::Gemm g{(const bf16*)(ws + WS_MSUM), (const bf16*)(ws + WS_WOUT), T, D, D, D, D}; pg8::StaticOrder S; S.init(T, D, G, wg);
            EpiResid E{xin, (float*)(ws + WS_Y)};
            auto S2 = MAKE_ORDER(6, S); pg8::gemm_phase<EpiResid, ORDER_T(6, pg8::StaticOrder), true, true>(lds, g, S2, E); } SEAM(6); }
        if (RUN(7)) { REP(7) { phase_ln1_router(p, l, lds, wg, G, wave, lane, (PROBE_DUP == 7 && _r == 0) ? 16384 : 0); } SEAM(7); }
        if (RUN(8)) { REP(8) { const unsigned* cnt = (const unsigned*)(ws + WS_CTL) + CW_CNT + l * 4096; MoeTab M(lds); moe_tables(M, cnt, tid, lane, wave);
            UpOrder S{M, 0}; S.n = up_order_build(M, (const int*)(ws + WS_LIST), (const float*)(ws + WS_WL), wg, G, tid);
            pg8::Gemm g{(const bf16*)(ws + WS_X1B), (const bf16*)(ws + WS_WUP), T, NEX * 1024, D, D, D};
            EpiGluSparse E{(LAS const float*)M.wt, (bf16*)(ws + WS_HB)};
            auto S2 = MAKE_ORDER(8, S); pg8::gemm_phase_gather<EpiGluSparse, ORDER_T(8, UpOrder)>(lds, g, S2, E); } SEAM(8); }
        if (RUN(9)) { REP(9) { const unsigned* cnt = (const unsigned*)(ws + WS_CTL) + CW_CNT + l * 4096; MoeTab M(lds); moe_tables(M, cnt, tid, lane, wave);
            DownOrder S{M, G, wg, 8 * M.t[65]};
            pg8::Gemm g{(const bf16*)(ws + WS_HB), (const bf16*)(ws + WS_WDN), HROWS, NEX * D, ED, ED, ED};
            EpiYexp E{(bf16*)(ws + WS_YEXP)};
            auto S2 = MAKE_ORDER(9, S); pg8::gemm_phase<EpiYexp, ORDER_T(9, DownOrder), true, true>(lds, g, S2, E); } SEAM(9); }
        if (RUN(10)) { REP(10) { phase_combine_ln2(p, l, xout, gw, NGW, lane); } SEAM(10); }
#undef RUN
#undef SEAM
    }
}
__global__ void __launch_bounds__(512, 2) fwd_kernel(Params p) {
    extern __shared__ __attribute__((aligned(16))) unsigned char lds_raw[];
    LAS unsigned char* lds = (LAS unsigned char*)lds_raw;
    const int tid = threadIdx.x, lane = tid & 63, wave = __builtin_amdgcn_readfirstlane(tid >> 6);
    const int G = gridDim.x, wg = blockIdx.x, gw = wg * 8 + wave, NGW = G * 8;
    volatile LAS unsigned* MISC = (volatile LAS unsigned*)(lds + MISC_OFF);
    if (tid < 32) MISC[tid] = 0u;
    __syncthreads();
    unsigned* ctl = (unsigned*)(p.ws + WS_CTL);
    const bool multi = (p.ph_hi - p.ph_lo) > 1;
    XcdBarrier bar; bar.bar = ctl + CW_BAR; bar.x = 0; bar.st = nullptr;
    if (multi) bar = xcd_barrier_post(ctl + CW_BAR, MISC + 8);
    run_layer<0>(p, lds, bar, tid, lane, wave, G, wg, gw, NGW);
    run_layer<1>(p, lds, bar, tid, lane, wave, G, wg, gw, NGW);
}

#ifndef MK_MULTI_LAUNCH
#define MK_MULTI_LAUNCH 0
#endif
extern "C" void kernel_launch(void* const* d_in, const int* in_sizes, int n_in, void* d_out, int out_size, void* d_ws, size_t ws_size, hipStream_t stream) {
    static int grid = 0;
    if (grid == 0) {
        if (n_in != 27 || out_size != T * D || ws_size < WS_END) { fprintf(stderr, "kernel_launch: unexpected shapes (n_in %d out %d ws %zu need %zu)\n", n_in, out_size, ws_size, (size_t)WS_END); grid = -1; return; }
        int dev = 0, cus = 0, per_cu = 0;
        if (hipGetDevice(&dev) != hipSuccess || hipDeviceGetAttribute(&cus, hipDeviceAttributeMultiprocessorCount, dev) != hipSuccess) { grid = -1; return; }
        if (hipFuncSetAttribute((const void*)fwd_kernel, hipFuncAttributeMaxDynamicSharedMemorySize, LDS_BYTES) != hipSuccess) { fprintf(stderr, "kernel_launch: hipFuncSetAttribute failed\n"); grid = -1; return; }
        if (hipOccupancyMaxActiveBlocksPerMultiprocessor(&per_cu, (const void*)fwd_kernel, 512, LDS_BYTES) != hipSuccess || per_cu < 1) { fprintf(stderr, "kernel_launch: occupancy query says %d\n", per_cu); }
        (void)hipGetLastError();
        grid = cus;
    }
    if (grid < 0) return;
    (void)hipMemsetAsync((char*)d_ws + WS_CTL, 0, CTL_ZERO_BYTES, stream);
    Params p{};
    for (int i = 0; i < 27; ++i) p.in[i] = (const float*)d_in[i];
    p.out = (float*)d_out; p.ws = (unsigned char*)d_ws;
#if MK_MULTI_LAUNCH
    for (int ph = 0; ph < NL * NPH; ++ph) { p.ph_lo = ph; p.ph_hi = ph + 1; hipLaunchKernelGGL(fwd_kernel, dim3(grid), dim3(512), LDS_BYTES, stream, p); }
#else
    p.ph_lo = 0; p.ph_hi = NL * NPH; hipLaunchKernelGGL(fwd_kernel, dim3(grid), dim3(512), LDS_BYTES, stream, p);
#endif
}
```

```cpp
#include <hip/hip_runtime.h>
#include <cstdio>
#include <cstdint>
#include <type_traits>
namespace pg8 {
#define PG8_LAS __attribute__((address_space(3)))
typedef unsigned short bf16_t;
typedef short bf16x8 __attribute__((ext_vector_type(8)));
typedef float f32x4 __attribute__((ext_vector_type(4)));
typedef unsigned u32x4 __attribute__((ext_vector_type(4)));
constexpr int BM = 256, BK = 64, HALF = 128, HTB = HALF * BK * 2  , STAGE_BYTES = 8 * HTB, NXCD = 8, WGM = 8;

__host__ __device__ __forceinline__ int lds_byte(int r, int c) { const int st = (r >> 4) * 2 + (c >> 5), rr = r & 15, cc = c & 31, ob = rr * 64 + cc * 2; return st * 1024 + (ob ^ (((ob >> 9) & 1) << 5)); }
__host__ __device__ __forceinline__ void stage_rc(int b, int& R, int& C) { const int st = b / 1024, sb = b % 1024, swz = sb ^ (((sb >> 9) & 1) << 5); R = (st >> 1) * 16 + swz / 64; C = (st & 1) * 32 + (swz % 64) / 2; }
__host__ __device__ __forceinline__ int perm32(int rho) { const int n = rho >> 4, i = rho & 15; return 8 * (i >> 2) + 4 * n + (i & 3); }

struct Unit { int pm, pn, aux; };
struct Gemm { const bf16_t* A; const bf16_t* Bt; int M, N, K, lda, ldb; };

struct StaticOrder {
    int nM, nN, nwg, G, c;
    __host__ __device__ void init(int M, int N, int G_, int c_) { nM = M / BM; nN = N / BM; nwg = nM * nN; G = G_; c = c_; }
    __host__ __device__ bool next(int i, Unit& u) const {
        const long L = (long)i * G + c; if (L >= nwg) return false;
        int wgid = (int)L; { const int q = nwg / NXCD, r = nwg % NXCD, xcd = wgid % NXCD, off = wgid / NXCD; wgid = (xcd < r ? xcd * (q + 1) : r * (q + 1) + (xcd - r) * q) + off; }
        const int nig = WGM * nN, gid = wgid / nig, fm = gid * WGM, gsz = (nM - fm) < WGM ? (nM - fm) : WGM;
        u.pm = fm + ((wgid % nig) % gsz); u.pn = (wgid % nig) / gsz; return true;
    }
    __device__ __forceinline__ void a_ready(const Unit&) const {}
    __device__ __forceinline__ void done(const Unit&) const {}
};

__device__ __forceinline__ unsigned cvt_pk_bf16(float lo, float hi) { unsigned r; asm volatile("v_cvt_pk_bf16_f32 %0, %1, %2" : "=v"(r) : "v"(lo), "v"(hi)); return r; }
typedef float f32x2 __attribute__((ext_vector_type(2)));
__device__ __forceinline__ f32x2 gelu_pk(f32x2 v) {
    const f32x2 av = __builtin_elementwise_abs(v), d = av * 0.2316418882f + 1.0f;
    f32x2 t; t.x = __builtin_amdgcn_rcpf(d.x); t.y = __builtin_amdgcn_rcpf(d.y);
    f32x2 q = t * 0.5307027145f + (-0.7265760135f); q = q * t + 0.7107068705f; q = q * t + (-0.142248368f); q = q * t + 0.127414796f; q = q * t;
    const f32x2 s = (v * v) * (-0.72134752044f);
    f32x2 e; e.x = __builtin_amdgcn_exp2f(s.x); e.y = __builtin_amdgcn_exp2f(s.y);
    const f32x2 m = v * (q * e), r = v - m;
    f32x2 o; o.x = v.x < 0.f ? m.x : r.x; o.y = v.y < 0.f ? m.y : r.y; return o;
}

template <int ACT  > struct EpiBf16 {
    static constexpr bool PERM = true, AFTER_DRAIN = false; static_assert(ACT == 0 || ACT == 1, "EpiBf16: ACT is 0 (none) or 1 (gelu_pk)");
    bf16_t* O; int ldc; const float* bias; int split_cols; size_t split_stride; float scale0;
    __device__ __forceinline__ void operator()(const f32x4 (&acc)[2][2][4][2], const Unit& u, int wr, int wc, int fr, int fq) const {
        const int row0 = u.pm * BM + wr * 64 + fr; int colt = u.pn * BM; bf16_t* base = O;
        float sc = scale0; if (split_cols) { const int t = colt / split_cols; base += (size_t)t * split_stride; colt -= t * split_cols; if (t != 0) sc = 1.f; }
        const int col0 = colt + wc * 32 + 8 * fq, bcol0 = u.pn * BM + wc * 32 + 8 * fq;
        f32x4 bv[2][2];
#pragma unroll
        for (int bj = 0; bj < 2; ++bj)
#pragma unroll
            for (int n = 0; n < 2; ++n) bv[bj][n] = bias ? *(const f32x4*)(bias + bcol0 + bj * HALF + 4 * n) : (f32x4){0.f, 0.f, 0.f, 0.f};
#pragma unroll
        for (int ai = 0; ai < 2; ++ai)
#pragma unroll
            for (int m = 0; m < 4; ++m) { bf16_t* rowp = base + (size_t)(row0 + ai * HALF + m * 16) * ldc + col0;
#pragma unroll
                for (int bj = 0; bj < 2; ++bj) { f32x4 v0 = acc[ai][bj][m][0] + bv[bj][0], v1 = acc[ai][bj][m][1] + bv[bj][1];
                    if (ACT == 1) { f32x2 a = gelu_pk((f32x2){v0[0], v0[1]}), b = gelu_pk((f32x2){v0[2], v0[3]}), c = gelu_pk((f32x2){v1[0], v1[1]}), d = gelu_pk((f32x2){v1[2], v1[3]});
                        v0 = (f32x4){a.x, a.y, b.x, b.y}; v1 = (f32x4){c.x, c.y, d.x, d.y}; }
                    v0 = v0 * sc; v1 = v1 * sc; u32x4 w; w.x = cvt_pk_bf16(v0[0], v0[1]); w.y = cvt_pk_bf16(v0[2], v0[3]); w.z = cvt_pk_bf16(v1[0], v1[1]); w.w = cvt_pk_bf16(v1[2], v1[3]);
                    *(u32x4*)(rowp + bj * HALF) = w; } }
    }
};

typedef int i32x8 __attribute__((ext_vector_type(8)));
__device__ __forceinline__ i32x8 cat8(const bf16x8 a, const bf16x8 b) { typedef int i32x4 __attribute__((ext_vector_type(4))); const i32x4 x = __builtin_bit_cast(i32x4, a), y = __builtin_bit_cast(i32x4, b); return (i32x8){x[0], x[1], x[2], x[3], y[0], y[1], y[2], y[3]}; }
__device__ __forceinline__ bf16x8 lo8(const i32x8 v) { typedef int i32x4 __attribute__((ext_vector_type(4))); return __builtin_bit_cast(bf16x8, __builtin_shufflevector(v, v, 0, 1, 2, 3)); }
__device__ __forceinline__ bf16x8 hi8(const i32x8 v) { typedef int i32x4 __attribute__((ext_vector_type(4))); return __builtin_bit_cast(bf16x8, __builtin_shufflevector(v, v, 4, 5, 6, 7)); }
template <class Epi, class Sched, bool ALIGN_EPI = false, bool SP2 = false, bool FP8 = false>
__device__ __forceinline__ void gemm_phase(PG8_LAS unsigned char* lds, const Gemm g, const Sched& S, const Epi& E) {
    const int tid = threadIdx.x, wid = __builtin_amdgcn_readfirstlane(tid >> 6), lane = tid & 63, wr = wid >> 2, wc = wid & 3, fr = lane & 15, fq = lane >> 4;
    const int K = g.K, nt = K / BK;
    unsigned voffA[2], voffB[2];
#pragma unroll
    for (int i = 0; i < 2; ++i) { int R, C; stage_rc(tid * 16 + i * 8192, R, C); const int Rb = Epi::PERM ? ((R & ~31) + perm32(R & 31)) : R;
        voffA[i] = (unsigned)(R * g.lda + C) * 2u; voffB[i] = (unsigned)(Rb * g.ldb + C) * 2u; }
    const size_t kstep = (size_t)(BK * 2);
    const size_t hstepA = (size_t)HALF * g.lda * 2, hstepB = (size_t)HALF * g.ldb * 2;
    const size_t tstepA = 2 * hstepA, tstepB = 2 * hstepB;
    const unsigned ldsw = (unsigned)wid * 1024u;
    const int aoff = lds_byte(wr * 64 + fr, fq * 8), boff = lds_byte(wc * 32 + fr, fq * 8);
#define PG8_SA(b, h) (((b) * 2 + (h)) * HTB)
#define PG8_SB(b, h) ((4 + (b) * 2 + (h)) * HTB)
#define PG8_STAGE(bufoff, gbase, voff) do { _Pragma("unroll") for (int _i = 0; _i < 2; ++_i) \
        __builtin_amdgcn_global_load_lds((const unsigned*)((const char*)(gbase) + (voff)[_i]), (PG8_LAS unsigned*)(lds + (bufoff) + ldsw + _i * 8192), 16, 0, 0); } while (0)
#define PG8_LDA(dst, b, h) do { _Pragma("unroll") for (int m = 0; m < 4; ++m) { if constexpr (FP8) dst##8[m] = cat8(*(const PG8_LAS bf16x8*)(lds + PG8_SA(b, h) + aoff + m * 2048), *(const PG8_LAS bf16x8*)(lds + PG8_SA(b, h) + aoff + m * 2048 + 1024)); \
        else { _Pragma("unroll") for (int k = 0; k < 2; ++k) dst[m][k] = *(const PG8_LAS bf16x8*)(lds + PG8_SA(b, h) + aoff + m * 2048 + k * 1024); } } } while (0)
#define PG8_LDB(dst, b, h) do { _Pragma("unroll") for (int n = 0; n < 2; ++n) { if constexpr (FP8) dst##8[n] = cat8(*(const PG8_LAS bf16x8*)(lds + PG8_SB(b, h) + boff + n * 2048), *(const PG8_LAS bf16x8*)(lds + PG8_SB(b, h) + boff + n * 2048 + 1024)); \
        else { _Pragma("unroll") for (int k = 0; k < 2; ++k) dst[n][k] = *(const PG8_LAS bf16x8*)(lds + PG8_SB(b, h) + boff + n * 2048 + k * 1024); } } } while (0)
#define PG8_MMA(ai, bj, At, Bt) do { __builtin_amdgcn_s_setprio(1); _Pragma("unroll") for (int m = 0; m < 4; ++m) _Pragma("unroll") for (int n = 0; n < 2; ++n) { \
        if constexpr (FP8) asm volatile("v_mfma_scale_f32_16x16x128_f8f6f4 %0, %1, %2, %0, %3, %3 op_sel_hi:[0,0,0]" : "+v"(acc[ai][bj][m][n]) : "v"(Bt##8[n]), "v"(At##8[m]), "v"(fp8_unit_scale)); \
        else { _Pragma("unroll") for (int k = 0; k < 2; ++k) acc[ai][bj][m][n] = __builtin_amdgcn_mfma_f32_16x16x32_bf16(Bt[n][k], At[m][k], acc[ai][bj][m][n], 0, 0, 0); } } __builtin_amdgcn_s_setprio(0); } while (0)
#define PG8_WAIT_V(n) asm volatile("s_waitcnt vmcnt(" #n ")" ::: "memory")
#define PG8_WAIT_L(n) asm volatile("s_waitcnt lgkmcnt(" #n ")" ::: "memory")
#define PG8_BAR __builtin_amdgcn_s_barrier()
#define PG8_SCHED __builtin_amdgcn_sched_barrier(0)
    Unit cur, nxt; int ui = 0;
    if (!S.next(0, cur)) return;
    f32x4 acc[2][2][4][2];
#pragma unroll
    for (int a = 0; a < 2; ++a)
#pragma unroll
        for (int b = 0; b < 2; ++b)
#pragma unroll
            for (int m = 0; m < 4; ++m)
#pragma unroll
                for (int n = 0; n < 2; ++n) acc[a][b][m][n] = (f32x4){0.f, 0.f, 0.f, 0.f};
    int fp8_unit_scale = 0x7F7F7F7F; asm volatile("" : "+v"(fp8_unit_scale));
    bf16x8 At[4][2], B0[2][2], B1[2][2];
    i32x8 At8[4], B08[2], B18[2];
    const char* cA = (const char*)g.A + (size_t)cur.pm * tstepA; const char* cB = (const char*)g.Bt + (size_t)cur.pn * tstepB;
    S.a_ready(cur);
    if constexpr (SP2) {
        PG8_STAGE(PG8_SB(0, 0), cB, voffB); PG8_STAGE(PG8_SB(0, 1), cB + hstepB, voffB); PG8_STAGE(PG8_SA(0, 0), cA, voffA); PG8_STAGE(PG8_SA(0, 1), cA + hstepA, voffA);
        if (wr == 1) PG8_BAR;
        PG8_WAIT_V(2); PG8_BAR;
        PG8_STAGE(PG8_SB(1, 0), cB + kstep, voffB); PG8_STAGE(PG8_SA(1, 0), cA + kstep, voffA); PG8_STAGE(PG8_SB(1, 1), cB + hstepB + kstep, voffB);
        PG8_WAIT_V(6); PG8_BAR;
    } else {
        PG8_STAGE(PG8_SB(0, 0), cB, voffB); PG8_STAGE(PG8_SA(0, 0), cA, voffA); PG8_STAGE(PG8_SB(0, 1), cB + hstepB, voffB); PG8_STAGE(PG8_SA(0, 1), cA + hstepA, voffA);
        if (wr == 1) PG8_BAR;
        PG8_WAIT_V(4); PG8_BAR;
        PG8_STAGE(PG8_SB(1, 0), cB + kstep, voffB); PG8_STAGE(PG8_SA(1, 0), cA + kstep, voffA); PG8_STAGE(PG8_SB(1, 1), cB + hstepB + kstep, voffB);
        PG8_WAIT_V(6); PG8_BAR;
    }
    for (;;) {
        const bool has_next = S.next(ui + 1, nxt);
        const char* nA = has_next ? (const char*)g.A + (size_t)nxt.pm * tstepA : cA; const char* nB = has_next ? (const char*)g.Bt + (size_t)nxt.pn * tstepB : cB;
        for (int t = 0; t < nt; t += 2) {
            const bool last = (t == nt - 2);
            const char* a1 = cA + (size_t)(t + 1) * kstep;
            const char* a2 = last ? nA : cA + (size_t)(t + 2) * kstep; const char* b2 = last ? nB : cB + (size_t)(t + 2) * kstep;
            const char* a3 = a2 + kstep; const char* b3 = b2 + kstep;
            if (last && has_next) S.a_ready(nxt);
            if constexpr (SP2) {
            PG8_LDB(B0, 0, 0); PG8_LDB(B1, 0, 1); PG8_SCHED; PG8_LDA(At, 0, 0); PG8_STAGE(PG8_SA(1, 1), a1 + hstepA, voffA);
            PG8_WAIT_V(8); PG8_WAIT_L(0); PG8_BAR; PG8_MMA(0, 0, At, B0); PG8_MMA(0, 1, At, B1); PG8_BAR; PG8_SCHED;
            PG8_LDA(At, 0, 1); PG8_STAGE(PG8_SB(0, 0), b2, voffB); PG8_STAGE(PG8_SB(0, 1), b2 + hstepB, voffB); PG8_STAGE(PG8_SA(0, 0), a2, voffA);
            PG8_WAIT_V(8); PG8_WAIT_L(0); PG8_BAR; PG8_MMA(1, 0, At, B0); PG8_MMA(1, 1, At, B1); PG8_BAR; PG8_SCHED;
            PG8_LDB(B0, 1, 0); PG8_LDB(B1, 1, 1); PG8_SCHED; PG8_LDA(At, 1, 0); PG8_STAGE(PG8_SA(0, 1), a2 + hstepA, voffA);
            PG8_WAIT_V(8); PG8_WAIT_L(0); PG8_BAR; PG8_MMA(0, 0, At, B0); PG8_MMA(0, 1, At, B1); PG8_BAR; PG8_SCHED;
            PG8_LDA(At, 1, 1); PG8_STAGE(PG8_SB(1, 0), b3, voffB); PG8_STAGE(PG8_SB(1, 1), b3 + hstepB, voffB); PG8_STAGE(PG8_SA(1, 0), a3, voffA);
            PG8_WAIT_V(8); PG8_WAIT_L(0); PG8_BAR; PG8_MMA(1, 0, At, B0); PG8_MMA(1, 1, At, B1); PG8_BAR; PG8_SCHED;
            } else {
            PG8_LDB(B0, 0, 0); PG8_SCHED; PG8_LDA(At, 0, 0); PG8_STAGE(PG8_SA(1, 1), a1 + hstepA, voffA);
            PG8_WAIT_L(8); PG8_BAR; PG8_WAIT_L(0); PG8_MMA(0, 0, At, B0); PG8_BAR; PG8_SCHED;
            PG8_LDB(B1, 0, 1); PG8_STAGE(PG8_SB(0, 0), b2, voffB);
            PG8_BAR; PG8_WAIT_L(0); PG8_MMA(0, 1, At, B1); PG8_BAR;
            PG8_LDA(At, 0, 1); PG8_STAGE(PG8_SA(0, 0), a2, voffA);
            PG8_BAR; PG8_WAIT_L(0); PG8_MMA(1, 0, At, B0); PG8_BAR; PG8_SCHED;
            PG8_STAGE(PG8_SB(0, 1), b2 + hstepB, voffB);
            PG8_WAIT_V(6); PG8_BAR; PG8_MMA(1, 1, At, B1); PG8_BAR;
            PG8_LDB(B0, 1, 0); PG8_SCHED; PG8_LDA(At, 1, 0); PG8_STAGE(PG8_SA(0, 1), a2 + hstepA, voffA);
            PG8_WAIT_L(8); PG8_BAR; PG8_WAIT_L(0); PG8_MMA(0, 0, At, B0); PG8_BAR; PG8_SCHED;
            PG8_LDB(B1, 1, 1); PG8_STAGE(PG8_SB(1, 0), b3, voffB);
            PG8_BAR; PG8_WAIT_L(0); PG8_MMA(0, 1, At, B1); PG8_BAR;
            PG8_LDA(At, 1, 1); PG8_STAGE(PG8_SA(1, 0), a3, voffA);
            PG8_BAR; PG8_WAIT_L(0); PG8_MMA(1, 0, At, B0); PG8_BAR; PG8_SCHED;
            PG8_STAGE(PG8_SB(1, 1), b3 + hstepB, voffB);
            PG8_WAIT_V(6); PG8_BAR; PG8_MMA(1, 1, At, B1); PG8_BAR;
            }
        }
        if constexpr (ALIGN_EPI) { if (wr == 0) PG8_BAR; }
        if constexpr (FP8) asm volatile("s_nop 7\n\ts_nop 7" ::: "memory");
        if constexpr (!Epi::AFTER_DRAIN) { E(acc, cur, wr, wc, fr, fq); S.done(cur); }
        if (!has_next) break;
#pragma unroll
        for (int a = 0; a < 2; ++a)
#pragma unroll
            for (int b = 0; b < 2; ++b)
#pragma unroll
                for (int m = 0; m < 4; ++m)
#pragma unroll
                    for (int n = 0; n < 2; ++n) acc[a][b][m][n] = (f32x4){0.f, 0.f, 0.f, 0.f};
        cur = nxt; cA = nA; cB = nB; ++ui;
        if constexpr (ALIGN_EPI) { if (wr == 1) PG8_BAR; }
    }
    PG8_WAIT_V(0);
    if constexpr (!ALIGN_EPI) { if (wr == 0) PG8_BAR; }
    PG8_BAR;
    if constexpr (Epi::AFTER_DRAIN) { E.fused(acc, cur, wr, wc, fr, fq, lds, wid, lane); S.done(cur); }
#undef PG8_SA
#undef PG8_SB
#undef PG8_STAGE
#undef PG8_LDA
#undef PG8_LDB
#undef PG8_MMA
#undef PG8_WAIT_V
#undef PG8_WAIT_L
#undef PG8_BAR
#undef PG8_SCHED
}
template <class Epi, class Sched>
__device__ __forceinline__ void gemm_phase_gather(PG8_LAS unsigned char* lds, const Gemm g, const Sched& S, const Epi& E) {
    const int tid = threadIdx.x, wid = __builtin_amdgcn_readfirstlane(tid >> 6), lane = tid & 63, wr = wid >> 2, wc = wid & 3, fr = lane & 15, fq = lane >> 4;
    const int K = g.K, nt = K / BK;
    unsigned voffB[2]; int RA[2], CA[2];
#pragma unroll
    for (int i = 0; i < 2; ++i) { int R, C; stage_rc(tid * 16 + i * 8192, R, C); const int Rb = Epi::PERM ? ((R & ~31) + perm32(R & 31)) : R;
        RA[i] = R; CA[i] = C; voffB[i] = (unsigned)(Rb * g.ldb + C) * 2u; }
    const size_t kstep = (size_t)(BK * 2);
    const size_t hstepB = (size_t)HALF * g.ldb * 2, tstepB = 2 * hstepB;
    const unsigned ldsw = (unsigned)wid * 1024u;
    const int aoff = lds_byte(wr * 64 + fr, fq * 8), boff = lds_byte(wc * 32 + fr, fq * 8);
#define PG8_SA(b, h) (((b) * 2 + (h)) * HTB)
#define PG8_SB(b, h) ((4 + (b) * 2 + (h)) * HTB)
#define PG8_STAGE(bufoff, gbase, voff) do { _Pragma("unroll") for (int _i = 0; _i < 2; ++_i) \
        __builtin_amdgcn_global_load_lds((const unsigned*)((const char*)(gbase) + (voff)[_i]), (PG8_LAS unsigned*)(lds + (bufoff) + ldsw + _i * 8192), 16, 0, 0); } while (0)
#define PG8_LDA(dst, b, h) do { _Pragma("unroll") for (int m = 0; m < 4; ++m) _Pragma("unroll") for (int k = 0; k < 2; ++k) dst[m][k] = *(const PG8_LAS bf16x8*)(lds + PG8_SA(b, h) + aoff + m * 2048 + k * 1024); } while (0)
#define PG8_LDB(dst, b, h) do { _Pragma("unroll") for (int n = 0; n < 2; ++n) _Pragma("unroll") for (int k = 0; k < 2; ++k) dst[n][k] = *(const PG8_LAS bf16x8*)(lds + PG8_SB(b, h) + boff + n * 2048 + k * 1024); } while (0)
#define PG8_MMA(ai, bj, At, Bt) do { __builtin_amdgcn_s_setprio(1); _Pragma("unroll") for (int m = 0; m < 4; ++m) _Pragma("unroll") for (int n = 0; n < 2; ++n) _Pragma("unroll") for (int k = 0; k < 2; ++k) \
        acc[ai][bj][m][n] = __builtin_amdgcn_mfma_f32_16x16x32_bf16(Bt[n][k], At[m][k], acc[ai][bj][m][n], 0, 0, 0); __builtin_amdgcn_s_setprio(0); } while (0)
#define PG8_WAIT_V(n) asm volatile("s_waitcnt vmcnt(" #n ")" ::: "memory")
#define PG8_WAIT_L(n) asm volatile("s_waitcnt lgkmcnt(" #n ")" ::: "memory")
#define PG8_BAR __builtin_amdgcn_s_barrier()
#define PG8_SCHED __builtin_amdgcn_sched_barrier(0)
#define PG8_ROWS(dst, ui_) do { _Pragma("unroll") for (int _h = 0; _h < 2; ++_h) _Pragma("unroll") for (int _i = 0; _i < 2; ++_i) \
        dst[_h][_i] = (unsigned)S.row_token((ui_), _h * HALF + RA[_i]) * (unsigned)(g.lda * 2) + (unsigned)(CA[_i] * 2); } while (0)
    Unit cur, nxt; int ui = 0;
    if (!S.next(0, cur)) return;
    f32x4 acc[2][2][4][2];
#pragma unroll
    for (int a = 0; a < 2; ++a)
#pragma unroll
        for (int b = 0; b < 2; ++b)
#pragma unroll
            for (int m = 0; m < 4; ++m)
#pragma unroll
                for (int n = 0; n < 2; ++n) acc[a][b][m][n] = (f32x4){0.f, 0.f, 0.f, 0.f};
    bf16x8 At[4][2], B0[2][2], B1[2][2];
    unsigned offC[2][2];
    PG8_ROWS(offC, 0);
    const char* gA = (const char*)g.A;
    const char* cB = (const char*)g.Bt + (size_t)cur.pn * tstepB;
    PG8_STAGE(PG8_SB(0, 0), cB, voffB); PG8_STAGE(PG8_SB(0, 1), cB + hstepB, voffB); PG8_STAGE(PG8_SA(0, 0), gA, offC[0]); PG8_STAGE(PG8_SA(0, 1), gA, offC[1]);
    if (wr == 1) PG8_BAR;
    PG8_WAIT_V(2); PG8_BAR;
    PG8_STAGE(PG8_SB(1, 0), cB + kstep, voffB); PG8_STAGE(PG8_SA(1, 0), gA + kstep, offC[0]); PG8_STAGE(PG8_SB(1, 1), cB + hstepB + kstep, voffB);
    PG8_WAIT_V(6); PG8_BAR;
    for (;;) {
        const bool has_next = S.next(ui + 1, nxt);
        const char* nB = has_next ? (const char*)g.Bt + (size_t)nxt.pn * tstepB : cB;
        for (int t = 0; t < nt; t += 2) {
            const bool last = (t == nt - 2);
            const char* a1 = gA + (size_t)(t + 1) * kstep;
            const char* a2 = last ? gA : gA + (size_t)(t + 2) * kstep; const char* b2 = last ? nB : cB + (size_t)(t + 2) * kstep;
            const char* a3 = a2 + kstep; const char* b3 = b2 + kstep;
            PG8_LDB(B0, 0, 0); PG8_LDB(B1, 0, 1); PG8_SCHED; PG8_LDA(At, 0, 0); PG8_STAGE(PG8_SA(1, 1), a1, offC[1]);
            if (last && has_next) { PG8_ROWS(offC, ui + 1); }
            PG8_WAIT_V(8); PG8_WAIT_L(0); PG8_BAR; PG8_MMA(0, 0, At, B0); PG8_MMA(0, 1, At, B1); PG8_BAR; PG8_SCHED;
            PG8_LDA(At, 0, 1); PG8_STAGE(PG8_SB(0, 0), b2, voffB); PG8_STAGE(PG8_SB(0, 1), b2 + hstepB, voffB); PG8_STAGE(PG8_SA(0, 0), a2, offC[0]);
            PG8_WAIT_V(8); PG8_WAIT_L(0); PG8_BAR; PG8_MMA(1, 0, At, B0); PG8_MMA(1, 1, At, B1); PG8_BAR; PG8_SCHED;
            PG8_LDB(B0, 1, 0); PG8_LDB(B1, 1, 1); PG8_SCHED; PG8_LDA(At, 1, 0); PG8_STAGE(PG8_SA(0, 1), a2, offC[1]);
            PG8_WAIT_V(8); PG8_WAIT_L(0); PG8_BAR; PG8_MMA(0, 0, At, B0); PG8_MMA(0, 1, At, B1); PG8_BAR; PG8_SCHED;
            PG8_LDA(At, 1, 1); PG8_STAGE(PG8_SB(1, 0), b3, voffB); PG8_STAGE(PG8_SB(1, 1), b3 + hstepB, voffB); PG8_STAGE(PG8_SA(1, 0), a3, offC[0]);
            PG8_WAIT_V(8); PG8_WAIT_L(0); PG8_BAR; PG8_MMA(1, 0, At, B0); PG8_MMA(1, 1, At, B1); PG8_BAR; PG8_SCHED;
        }
        if (wr == 0) PG8_BAR;
        E(acc, cur, wr, wc, fr, fq); S.done(cur);
        if (!has_next) break;
#pragma unroll
        for (int a = 0; a < 2; ++a)
#pragma unroll
            for (int b = 0; b < 2; ++b)
#pragma unroll
                for (int m = 0; m < 4; ++m)
#pragma unroll
                    for (int n = 0; n < 2; ++n) acc[a][b][m][n] = (f32x4){0.f, 0.f, 0.f, 0.f};
        cur = nxt; cB = nB; ++ui;
        if (wr == 1) PG8_BAR;
    }
    PG8_WAIT_V(0);
    PG8_BAR;
#undef PG8_ROWS
#undef PG8_SA
#undef PG8_SB
#undef PG8_STAGE
#undef PG8_LDA
#undef PG8_LDB
#undef PG8_MMA
#undef PG8_WAIT_V
#undef PG8_WAIT_L
#undef PG8_BAR
#undef PG8_SCHED
}
}

#ifndef PROBE_NOATOM
#define PROBE_NOATOM 0
#endif
constexpr int T = 8192, D = 2048, NL = 2, BW = 512, ZC = 14336, INC = 14352;
constexpr int NE = 64, NEX = 65  , ED = 512;
constexpr int HK = NEX * ED;
constexpr float ALPHA = 1.41421356237f;
constexpr float LN_EPS = 1e-5f;
constexpr int ZC_SBQ = 0, ZC_SBK = 512, ZC_SBV = 1024, ZC_GMU = 1536, ZC_GMV = 2048, ZC_GDN = 2560, ZC_GDNG = 4096,
              ZC_MLQ = 4608, ZC_MLK = 4864, ZC_MLV = 5120, ZC_MLO = 5632, ZC_GATE = 6144;

#define GAS __attribute__((address_space(1)))
#define LAS __attribute__((address_space(3)))
typedef unsigned short bf16;
typedef unsigned v4u __attribute__((ext_vector_type(4)));
typedef unsigned v2u __attribute__((ext_vector_type(2)));
typedef float v4f __attribute__((ext_vector_type(4)));
typedef float v2f __attribute__((ext_vector_type(2)));
#define LDS_WAIT() asm volatile("s_waitcnt lgkmcnt(0)" ::: "memory")
#define LDS_BAR() do { asm volatile("s_waitcnt lgkmcnt(0)" ::: "memory"); __builtin_amdgcn_s_barrier(); asm volatile("" ::: "memory"); } while (0)

constexpr size_t MiB = 1u << 20;
constexpr size_t WS_CTL = 0, CTL_ZERO_BYTES = 1 * MiB;
constexpr size_t WS_WIN = 2 * MiB, WS_WBR = 58 * MiB, WS_WOUT = 66 * MiB, WS_WUP = 74 * MiB, WS_WDN = 334 * MiB;
constexpr size_t WS_XB = 464 * MiB, WS_SMALL = 496 * MiB, WS_EG = 497 * MiB, WS_BETA = WS_EG + 256 * 1024, WS_COMB = 498 * MiB;
constexpr size_t WS_Z = 500 * MiB, WS_GQ = 724 * MiB, WS_GK = 740 * MiB, WS_GV = 756 * MiB, WS_GO = 772 * MiB, WS_HO = 788 * MiB;
constexpr size_t WS_BR = 804 * MiB, WS_MTMP = 836 * MiB, WS_MSUM = 900 * MiB, WS_Y = 932 * MiB, WS_X1 = 996 * MiB, WS_X1B = 1060 * MiB;
constexpr size_t WS_XCUR = 1092 * MiB, WS_HB = 1156 * MiB, WS_YEXP = 1236 * MiB, WS_LIST = 1524 * MiB, WS_WL = 1526 * MiB, WS_SLOT = 1528 * MiB, WS_MQ = 1530 * MiB, WS_MS = 1534 * MiB, WS_MK = 1538 * MiB, WS_MV = 1542 * MiB, WS_MFL = 1552 * MiB, WS_HDEN = WS_MFL + 65536, WS_VT = 1553 * MiB, WS_END = 1561 * MiB;
constexpr size_t WS_GU = WS_GQ, WS_GNW = WS_GK, WS_GQG = WS_GK + 8 * MiB, WS_GKT = WS_GV, WS_GAT = WS_GV + 8 * MiB, WS_GDL = WS_GV + 12 * MiB;
constexpr int HROWS = 73728;
static_assert(WS_HB + (size_t)HROWS * ED * 2 <= WS_YEXP && WS_YEXP + (size_t)HROWS * D * 2 <= WS_LIST, "ws map (moe)");
static_assert(WS_WIN + (size_t)ZC * D * 2 <= WS_WBR && WS_WUP + (size_t)NEX * 1024 * D * 2 <= WS_WDN && WS_WDN + (size_t)D * HK * 2 <= WS_XB, "ws map (weights)");
static_assert(WS_Z + (size_t)T * ZC * 2 <= WS_GQ, "ws map (acts)");
constexpr int CW_BAR = 4096, CW_CNT = 16384;
constexpr int TAB_OFF = 131072 + 1024;
constexpr int LDS_BYTES = 163840, MISC_OFF = 131072 + 320;

__device__ __forceinline__ float bflo(unsigned w) { return __uint_as_float(w << 16); }
__device__ __forceinline__ float bfhi(unsigned w) { return __uint_as_float(w & 0xffff0000u); }
__device__ __forceinline__ unsigned f2bf(float f) { unsigned u = __float_as_uint(f); return (u + 0x7fffu + ((u >> 16) & 1u)) >> 16; }
__device__ __forceinline__ unsigned pk2(float lo, float hi) { return f2bf(lo) | (f2bf(hi) << 16); }
template <int CTRL> __device__ __forceinline__ float dpp(float x) { return __builtin_bit_cast(float, __builtin_amdgcn_mov_dpp(__builtin_bit_cast(int, x), CTRL, 0xf, 0xf, true)); }
__device__ __forceinline__ float sum4(float x) { x += dpp<0xB1>(x); x += dpp<0x4E>(x); return x; }
__device__ __forceinline__ float sum8(float x) { x = sum4(x); x += dpp<0x141>(x); return x; }
__device__ __forceinline__ float sum16(float x) { x = sum8(x); x += dpp<0x140>(x); return x; }
__device__ __forceinline__ float wave_sum(float x) { x = sum16(x); x += __shfl_xor(x, 16); x += __shfl_xor(x, 32); return x; }
__device__ __forceinline__ float max8(float x) { x = fmaxf(x, dpp<0xB1>(x)); x = fmaxf(x, dpp<0x4E>(x)); x = fmaxf(x, dpp<0x141>(x)); return x; }
__device__ __forceinline__ float min8(float x) { x = fminf(x, dpp<0xB1>(x)); x = fminf(x, dpp<0x4E>(x)); x = fminf(x, dpp<0x141>(x)); return x; }
__device__ __forceinline__ float wave_scan_incl(float v) {
    v += __builtin_bit_cast(float, __builtin_amdgcn_update_dpp(0, __builtin_bit_cast(int, v), 0x111, 0xf, 0xf, true));
    v += __builtin_bit_cast(float, __builtin_amdgcn_update_dpp(0, __builtin_bit_cast(int, v), 0x112, 0xf, 0xf, true));
    v += __builtin_bit_cast(float, __builtin_amdgcn_update_dpp(0, __builtin_bit_cast(int, v), 0x114, 0xf, 0xf, true));
    v += __builtin_bit_cast(float, __builtin_amdgcn_update_dpp(0, __builtin_bit_cast(int, v), 0x118, 0xf, 0xf, true));
    v += __builtin_bit_cast(float, __builtin_amdgcn_update_dpp(0, __builtin_bit_cast(int, v), 0x142, 0xa, 0xf, false));
    v += __builtin_bit_cast(float, __builtin_amdgcn_update_dpp(0, __builtin_bit_cast(int, v), 0x143, 0xc, 0xf, false));
    return v;
}
__device__ __forceinline__ float sigmoidf_(float x) { return 1.f / (1.f + __expf(-x)); }
__device__ __forceinline__ float siluf_(float x) { return x / (1.f + __expf(-x)); }
__device__ __forceinline__ float softplusf_(float x) { return fmaxf(x, 0.f) + __logf(1.f + __expf(-fabsf(x))); }
__device__ __forceinline__ float gelu_tanh(float x) { const float y = 0.7978845608f * (x + 0.044715f * x * x * x); const float t = 1.f - 2.f / (__expf(2.f * y) + 1.f); return 0.5f * x * (1.f + t); }
__device__ __forceinline__ void unpack8(const v4u r, float (&f)[8]) { f[0] = bflo(r.x); f[1] = bfhi(r.x); f[2] = bflo(r.y); f[3] = bfhi(r.y); f[4] = bflo(r.z); f[5] = bfhi(r.z); f[6] = bflo(r.w); f[7] = bfhi(r.w); }
#define XB_TMO      128
#define XB_XCNT(j)  (256  + 64 * (j))
#define XB_XSUB(j)  (1280 + 64 * (j))
#define XB_XGEN(j)  (2304 + 64 * (j))
#define XB_TOP      3328
#define XB_TOPGEN   3392
#define XCD_BAR_WORDS 3456
#define XB_SPIN_CAP (1u << 18)

__device__ __forceinline__ unsigned xb_ld(unsigned* p)              { return __hip_atomic_load(p, __ATOMIC_RELAXED, __HIP_MEMORY_SCOPE_AGENT); }
__device__ __forceinline__ unsigned xb_add(unsigned* p, unsigned v) { return __hip_atomic_fetch_add(p, v, __ATOMIC_RELAXED, __HIP_MEMORY_SCOPE_AGENT); }
__device__ __forceinline__ unsigned xb_xcc_id() { return (unsigned)__builtin_amdgcn_s_getreg((3 << 11) | 20) & 0xFu; }
#define XB_SPIN(cond, bar) do { unsigned _sp = 0; while (cond) { __builtin_amdgcn_s_sleep(1); \
    if ((++_sp & 255u) == 0u) { if (xb_ld(&(bar)[XB_TMO])) break; if (_sp > XB_SPIN_CAP) { atomicAdd(&(bar)[XB_TMO], 1u); break; } } } } while (0)

struct XcdBarrier {
    unsigned* bar; unsigned x;
    volatile LAS unsigned* st;
};

__device__ __forceinline__ XcdBarrier xcd_barrier_post(unsigned* bar, volatile LAS unsigned* st) {
    XcdBarrier b; b.bar = bar; b.x = xb_xcc_id(); b.st = st;
    if (threadIdx.x == 0) (void)xb_add(&bar[XB_XCNT(b.x)], 1u);
    return b;
}
__device__ __forceinline__ void xcd_barrier_complete(unsigned* bar, unsigned x, unsigned& nloc, unsigned& nx) {
    const unsigned G = gridDim.x * gridDim.y * gridDim.z;
    unsigned sum, cnt, mine, sp = 0u;
    for (;;) {
        sum = 0u; cnt = 0u; mine = 0u;
#pragma unroll
        for (unsigned j = 0; j < 16; ++j) { const unsigned c = xb_ld(&bar[XB_XCNT(j)]); sum += c; cnt += (c > 0u) ? 1u : 0u; mine = (j == x) ? c : mine; }
        if (sum == G) break;
        __builtin_amdgcn_s_sleep(1);
        if ((++sp & 255u) == 0u) { if (xb_ld(&bar[XB_TMO])) break; if (sp > XB_SPIN_CAP) { atomicAdd(&bar[XB_TMO], 1u); break; } }
    }
    nloc = mine > 0u ? mine : 1u; nx = cnt > 0u ? cnt : 1u;
}

__device__ __forceinline__ void xcd_barrier(const XcdBarrier& b) {
    asm volatile("s_waitcnt vmcnt(0)" ::: "memory");
    __syncthreads();
    if (threadIdx.x == 0) {
        unsigned* bar = b.bar;
        __builtin_amdgcn_s_waitcnt(0);
        unsigned nloc = b.st[0], nx = b.st[1];
        if (nloc == 0u) { xcd_barrier_complete(bar, b.x, nloc, nx); b.st[0] = nloc; b.st[1] = nx; }
        const unsigned old = xb_add(&bar[XB_XSUB(b.x)], 1u);
        const unsigned gen = old / nloc;
        if (old + 1u == (gen + 1u) * nloc) {
            __builtin_amdgcn_fence(__ATOMIC_RELEASE, "agent");
            asm volatile("s_waitcnt vmcnt(0)" ::: "memory");
            const unsigned og = xb_add(&bar[XB_TOP], 1u);
            const unsigned tg = og / nx;
            if (og + 1u == (tg + 1u) * nx) xb_add(&bar[XB_TOPGEN], 1u);
            else XB_SPIN(xb_ld(&bar[XB_TOPGEN]) == tg, bar);
            __builtin_amdgcn_fence(__ATOMIC_ACQUIRE, "agent");
            xb_add(&bar[XB_XGEN(b.x)], 1u);
            asm volatile("s_waitcnt vmcnt(0)" ::: "memory");
        } else {
            XB_SPIN(xb_ld(&bar[XB_XGEN(b.x)]) == gen, bar);
            __builtin_amdgcn_fence(__ATOMIC_ACQUIRE, "agent");
            asm volatile("s_waitcnt vmcnt(0)" ::: "memory");
        }
    }
    __syncthreads();
}

struct Params { const float* in[27]; float* out; unsigned char* ws; int ph_lo, ph_hi; };
enum { I_X = 0, I_WIN, I_GMNG, I_GMNB, I_GMWS, I_GMBS, I_CONVW, I_ALOG, I_DTB, I_GDNNG, I_MLIB, I_MLFB, I_MLNG, I_WBR, I_WOUT, I_LN1G, I_LN1B,
       I_WR, I_RB, I_WG, I_WU, I_WD, I_SG, I_SU, I_SD, I_LN2G, I_LN2B };

using pg8::f32x4; using pg8::u32x4; using pg8::Unit; using pg8::HALF; using pg8::BM;

struct MergeOrder {
    int G, c;
    __device__ bool next(int i, Unit& u) const {
        const long L = (long)(i >> 2) * G + c; if (L >= 256) return false;
        const int g = i & 3; int wgid = (int)L; { const int q = 256 / 8, xcd = wgid % 8, off = wgid / 8; wgid = xcd * q + off; }
        const int nN = 8, nig = 8 * nN, gid = wgid / nig, fm = gid * 8; const int pm = fm + ((wgid % nig) % 8), pn = (wgid % nig) / 8;
        u.pm = g * 32 + pm; u.pn = g * 8 + pn; return true;
    }
    __device__ __forceinline__ void a_ready(const Unit&) const {}
    __device__ __forceinline__ void done(const Unit&) const {}
};
struct EpiMerge {
    static constexpr bool PERM = true, AFTER_DRAIN = false;
    const bf16* Z; float* tmp; bf16* msum;
    __device__ __forceinline__ void operator()(const f32x4 (&acc)[2][2][4][2], const Unit& u, int wr, int wc, int fr, int fq) const {
        const int g = u.pm >> 5, pm = u.pm & 31, pn = u.pn & 7;
        const int row0 = pm * BM + wr * 64 + fr, col0 = pn * BM + wc * 32 + 8 * fq;
#pragma unroll
        for (int ai = 0; ai < 2; ++ai)
#pragma unroll
            for (int m = 0; m < 4; ++m) { const size_t row = (size_t)(row0 + ai * HALF + m * 16);
#pragma unroll
                for (int bj = 0; bj < 2; ++bj) { const int col = col0 + bj * HALF;
                    const v4u gr = *(const v4u*)(Z + row * ZC + ZC_GATE + g * D + col); float gl[8]; unpack8(gr, gl);
                    float* tp = tmp + row * D + col; f32x4 v0 = acc[ai][bj][m][0], v1 = acc[ai][bj][m][1];
#pragma unroll
                    for (int j = 0; j < 4; ++j) { v0[j] *= sigmoidf_(gl[j]); v1[j] *= sigmoidf_(gl[4 + j]); }
                    if (g > 0) { v0 += *(const f32x4*)tp; v1 += *(const f32x4*)(tp + 4); }
                    if (g < 3) { *(f32x4*)tp = v0; *(f32x4*)(tp + 4) = v1; }
                    else { u32x4 w; w.x = pk2(v0[0], v0[1]); w.y = pk2(v0[2], v0[3]); w.z = pk2(v1[0], v1[1]); w.w = pk2(v1[2], v1[3]); *(u32x4*)(msum + row * D + col) = w; } }
                asm volatile("" ::: "memory"); }
    }
};
struct EpiResid {
    static constexpr bool PERM = false, AFTER_DRAIN = false;
    const float* X; float* Y;
    __device__ __forceinline__ void operator()(const f32x4 (&acc)[2][2][4][2], const Unit& u, int wr, int wc, int fr, int fq) const {
        const int row0 = u.pm * BM + wr * 64 + fr, col0 = u.pn * BM + wc * 32 + 4 * fq;
#pragma unroll
        for (int ai = 0; ai < 2; ++ai)
#pragma unroll
            for (int m = 0; m < 4; ++m) { const size_t off = (size_t)(row0 + ai * HALF + m * 16) * D + col0;
#pragma unroll
                for (int bj = 0; bj < 2; ++bj)
#pragma unroll
                    for (int n = 0; n < 2; ++n) { const f32x4 xv = *(const f32x4*)(X + off + bj * HALF + n * 16); *(f32x4*)(Y + off + bj * HALF + n * 16) = xv * ALPHA + acc[ai][bj][m][n]; } }
    }
};
struct MoeTab {
    LAS int* t; LAS unsigned short* tok; LAS float* wt; LAS unsigned char* mte;
    __device__ __forceinline__ MoeTab(LAS unsigned char* lds) : t((LAS int*)(lds + TAB_OFF)), tok((LAS unsigned short*)(lds + TAB_OFF + 1024)), wt((LAS float*)(lds + TAB_OFF + 5120)), mte((LAS unsigned char*)(lds + TAB_OFF + 13312)) {}
};
__device__ __forceinline__ void moe_tables(const MoeTab& M, const unsigned* cnt  , int tid, int lane, int wave) {
    __syncthreads();
    if (wave == 0) { const int c = (int)cnt[64 * lane]; const int tiles = (c + 255) >> 8; const float incl = wave_scan_incl((float)tiles);
        M.t[80 + lane] = c; M.t[lane] = (int)incl - tiles; if (lane == 63) { M.t[64] = (int)incl; M.t[65] = (int)incl + T / 256; M.t[80 + 64] = T; } }
    __syncthreads();
    const int Mt = M.t[65];
    for (int mt = tid; mt < Mt; mt += 512) { int e = 0;
        for (int k = 1; k <= 64; ++k) e = (M.t[k] <= mt) ? k : e;
        M.mte[mt] = (unsigned char)e; }
    __syncthreads();
}
struct UpOrder {
    MoeTab M; int n;
    __device__ __forceinline__ bool next(int i, Unit& u) const { if (i >= n) return false; u.pm = M.t[168 + i]; u.pn = M.t[176 + i]; u.aux = i; return true; }
    __device__ __forceinline__ int row_token(int i, int r) const { return (int)M.tok[i * 256 + r]; }
    __device__ __forceinline__ void a_ready(const Unit&) const {}
    __device__ __forceinline__ void done(const Unit&) const {}
};
__device__ __forceinline__ int up_order_build(const MoeTab& M, const int* LIST, const float* WL, int wg, int G, int tid) {
    const int U = 4 * M.t[65];
    if (tid < 8) { const int L = tid * G + wg; if (L < U) { const int mt = L >> 2, q = L & 3, e = M.mte[mt]; M.t[168 + tid] = mt; M.t[176 + tid] = e * 4 + q; M.t[184 + tid] = e; M.t[192 + tid] = mt - M.t[e]; } }
    int n = 0;
#pragma unroll
    for (int i = 0; i < 8; ++i) n += (i * G + wg < U) ? 1 : 0;
    __syncthreads();
    for (int idx = tid; idx < n * 256; idx += 512) { const int i = idx >> 8, r = idx & 255, e = M.t[184 + i], li = M.t[192 + i] * 256 + r;
        int tk = 0; float w = 0.f;
        if (e < NE) { if (li < M.t[80 + e]) { tk = LIST[e * T + li]; w = WL[e * T + li]; } } else { tk = li; w = 1.f; }
        M.tok[idx] = (unsigned short)tk; M.wt[idx] = w; }
    __syncthreads();
    return n;
}
struct EpiGluSparse {
    static constexpr bool PERM = true, AFTER_DRAIN = false;
    LAS const float* wt; bf16* H;
    __device__ __forceinline__ void operator()(const f32x4 (&acc)[2][2][4][2], const Unit& u, int wr, int wc, int fr, int fq) const {
        const int q = u.pn & 3; const int rl0 = wr * 64 + fr, col0 = q * 128 + wc * 32 + 8 * fq;
#pragma unroll
        for (int ai = 0; ai < 2; ++ai)
#pragma unroll
            for (int m = 0; m < 4; ++m) { const int rl = rl0 + ai * HALF + m * 16; const float c = wt[u.aux * 256 + rl]; float h[8];
#pragma unroll
                for (int n = 0; n < 2; ++n)
#pragma unroll
                    for (int j = 0; j < 4; ++j) h[4 * n + j] = siluf_(acc[ai][0][m][n][j]) * acc[ai][1][m][n][j] * c;
                u32x4 w; w.x = pk2(h[0], h[1]); w.y = pk2(h[2], h[3]); w.z = pk2(h[4], h[5]); w.w = pk2(h[6], h[7]);
                *(u32x4*)(H + ((size_t)u.pm * 256 + rl) * ED + col0) = w; }
    }
};
struct DownOrder {
    MoeTab M; int G, c, U;
    __device__ __forceinline__ bool next(int i, Unit& u) const { const int L = i * G + c; if (L >= U) return false; const int mt = L >> 3; u.pm = mt; u.pn = (int)M.mte[mt] * 8 + (L & 7); u.aux = 0; return true; }
    __device__ __forceinline__ void a_ready(const Unit&) const {}
    __device__ __forceinline__ void done(const Unit&) const {}
};
struct EpiYexp {
    static constexpr bool PERM = true, AFTER_DRAIN = false;
    bf16* Y;
    __device__ __forceinline__ void operator()(const f32x4 (&acc)[2][2][4][2], const Unit& u, int wr, int wc, int fr, int fq) const {
        const int row0 = u.pm * BM + wr * 64 + fr, col0 = (u.pn & 7) * BM + wc * 32 + 8 * fq;
#pragma unroll
        for (int ai = 0; ai < 2; ++ai)
#pragma unroll
            for (int m = 0; m < 4; ++m) { bf16* rowp = Y + (size_t)(row0 + ai * HALF + m * 16) * D + col0;
#pragma unroll
                for (int bj = 0; bj < 2; ++bj) { const f32x4 v0 = acc[ai][bj][m][0], v1 = acc[ai][bj][m][1];
                    u32x4 w; w.x = pk2(v0[0], v0[1]); w.y = pk2(v0[2], v0[3]); w.z = pk2(v1[0], v1[1]); w.w = pk2(v1[2], v1[3]); *(u32x4*)(rowp + bj * HALF) = w; } }
    }
};

struct TrItem { const float* src; bf16* dst; unsigned sld, dld; int f8; };
__device__ __forceinline__ void tr_load(const TrItem& t, int lane, v4f (&v)[8]) { const int r8 = lane >> 3, c4 = lane & 7;
#pragma unroll
    for (int i = 0; i < 8; ++i) v[i] = *(const v4f*)(t.src + (size_t)(8 * i + r8) * t.sld + 4 * c4); }
__device__ __forceinline__ void tr_store(const TrItem& t, const v4f (&v)[8], LAS float* scr, int lane) {
    { const int r8 = lane >> 3, c4 = lane & 7;
#pragma unroll
      for (int i = 0; i < 8; ++i) { LAS float* d = scr + (8 * i + r8) * 33 + 4 * c4; d[0] = v[i].x; d[1] = v[i].y; d[2] = v[i].z; d[3] = v[i].w; } }
    LDS_WAIT(); asm volatile("" ::: "memory");
    if (t.f8) {
        const int c = lane & 3;
#pragma unroll
        for (int j = 0; j < 2; ++j) { const int n = (lane >> 2) + 16 * j; const LAS float* s = scr + (16 * c) * 33 + n; unsigned w[4];
#pragma unroll
            for (int q = 0; q < 4; ++q) { unsigned x = 0; x = __builtin_amdgcn_cvt_pk_fp8_f32(s[(4 * q) * 33] * 64.f, s[(4 * q + 1) * 33] * 64.f, x, false); x = __builtin_amdgcn_cvt_pk_fp8_f32(s[(4 * q + 2) * 33] * 64.f, s[(4 * q + 3) * 33] * 64.f, x, true); w[q] = x; }
            *(v4u*)((unsigned char*)t.dst + (size_t)n * t.dld + 16 * c) = (v4u){w[0], w[1], w[2], w[3]}; }
    } else {
        const int c = lane & 7;
#pragma unroll
        for (int j = 0; j < 4; ++j) { const int n = (lane >> 3) + 8 * j; const LAS float* s = scr + (8 * c) * 33 + n;
            v4u o; o.x = pk2(s[0 * 33], s[1 * 33]); o.y = pk2(s[2 * 33], s[3 * 33]); o.z = pk2(s[4 * 33], s[5 * 33]); o.w = pk2(s[6 * 33], s[7 * 33]);
            *(v4u*)(t.dst + (size_t)n * t.dld + 8 * c) = o; }
    }
    LDS_WAIT(); asm volatile("" ::: "memory");
}
template <int PART> __device__ __forceinline__ TrItem tr_decode(const Params& p, int l, int it) {
    unsigned char* ws = p.ws;
    constexpr int N_IN = (ZC / 32) * (D / 64), N_BR = 4 * (BW / 64) * (D / 32), N_OUT = (D / 64) * (D / 32), N_UP = NEX * 2 * (D / 64) * (ED / 32);
    int r = it; TrItem t; t.f8 = 0;
    if (PART == 0) {
        const float* w_in = p.in[I_WIN] + (size_t)l * D * INC; const float* w_br = p.in[I_WBR] + (size_t)l * 4 * BW * D; const float* w_out = p.in[I_WOUT] + (size_t)l * D * D;
        bf16* WIN = (bf16*)(ws + WS_WIN); bf16* WBR = (bf16*)(ws + WS_WBR); bf16* WOUT = (bf16*)(ws + WS_WOUT);
        if (r < N_IN) { const int kb = r / (ZC / 32), n0 = (r % (ZC / 32)) * 32, k0 = kb * 64; const int sc = n0 + (n0 >= ZC_GATE ? 16 : (n0 >= ZC_MLQ ? 8 : 0));
            t.src = w_in + (size_t)k0 * INC + sc; t.sld = INC; t.dst = (bf16*)((unsigned char*)WIN + (size_t)n0 * D + k0); t.dld = D; t.f8 = 1; return t; } r -= N_IN;
        if (r < N_BR) { const int g = r / 512, rr = r % 512, k0 = (rr / 64) * 64, n0 = (rr % 64) * 32;
            t.src = w_br + ((size_t)g * BW + k0) * D + n0; t.sld = D; t.dst = WBR + ((size_t)g * D + n0) * BW + k0; t.dld = BW; return t; } r -= N_BR;
        { const int k0 = (r / 64) * 64, n0 = (r % 64) * 32; t.src = w_out + (size_t)k0 * D + n0; t.sld = D; t.dst = WOUT + (size_t)n0 * D + k0; t.dld = D; return t; }
    } else {
        const float* w_g = p.in[I_WG] + (size_t)l * NE * D * ED; const float* w_u = p.in[I_WU] + (size_t)l * NE * D * ED; const float* w_d = p.in[I_WD] + (size_t)l * NE * ED * D;
        const float* s_g = p.in[I_SG] + (size_t)l * D * ED; const float* s_u = p.in[I_SU] + (size_t)l * D * ED; const float* s_d = p.in[I_SD] + (size_t)l * ED * D;
        bf16* WUP = (bf16*)(ws + WS_WUP); bf16* WDN = (bf16*)(ws + WS_WDN);
        if (r < N_UP) { const int e = r / 1024, rr = r % 1024, mat = rr / 512, r2 = rr % 512, k0 = (r2 / 16) * 64, n0 = (r2 % 16) * 32;
            const float* sb = (e < NE) ? ((mat ? w_u : w_g) + (size_t)e * D * ED) : (mat ? s_u : s_g);
            const int drow = e * 1024 + (n0 / 128) * 256 + mat * 128 + (n0 % 128);
            t.src = sb + (size_t)k0 * ED + n0; t.sld = ED; t.dst = WUP + (size_t)drow * D + k0; t.dld = D; return t; } r -= N_UP;
        { const int e = r / 512, rr = r % 512, k0 = (rr / 64) * 64, n0 = (rr % 64) * 32;
            const float* sb = (e < NE) ? (w_d + (size_t)e * ED * D) : s_d;
            t.src = sb + (size_t)k0 * D + n0; t.sld = D; t.dst = WDN + ((size_t)e * D + n0) * ED + k0; t.dld = ED; return t; }
    }
}
template <int PART> __device__ __forceinline__ void phase_convert(const Params& p, int l, LAS unsigned char* lds, int gw, int NGW, int wave, int lane) {
    constexpr int N_IN = (ZC / 32) * (D / 64), N_BR = 4 * (BW / 64) * (D / 32), N_OUT = (D / 64) * (D / 32), N_UP = NEX * 2 * (D / 64) * (ED / 32), N_DN = NEX * (ED / 64) * (D / 32);
    constexpr int NITEMS = (PART == 0) ? (N_IN + N_BR + N_OUT) : (N_UP + N_DN);
    LAS float* scr = (LAS float*)(lds + wave * 16384);
    if (gw >= NITEMS) return;
    TrItem cur = tr_decode<PART>(p, l, gw); v4f va[8], vb[8];
    tr_load(cur, lane, va);
    for (int it = gw; it < NITEMS; it += 2 * NGW) {
        const int i1 = it + NGW, i2 = it + 2 * NGW; TrItem nx = cur;
        if (i1 < NITEMS) { nx = tr_decode<PART>(p, l, i1); } tr_load(nx, lane, vb);
        tr_store(cur, va, scr, lane);
        if (i1 >= NITEMS) break;
        cur = nx; if (i2 < NITEMS) { cur = tr_decode<PART>(p, l, i2); } tr_load(cur, lane, va);
        tr_store(nx, vb, scr, lane);
        if (i2 >= NITEMS) break;
    }
}
__device__ __forceinline__ void phase_xprep(const Params& p, int l, const float* xin, LAS unsigned char* lds, int gw, int NGW, int tid, int lane) {
    const float* w_in = p.in[I_WIN] + (size_t)l * D * INC; LAS float* wsm = (LAS float*)lds;
    __syncthreads();
    for (int idx = tid; idx < D * 16; idx += 512) { const int d = idx >> 4, c = idx & 15; wsm[c * D + d] = w_in[(size_t)d * INC + (c < 8 ? 4608 + c : 6152 + (c - 8))]; }
    __syncthreads();
    bf16* XB = (bf16*)(p.ws + WS_XB); float* SMALL = (float*)(p.ws + WS_SMALL);
    for (int m = gw; m < T; m += NGW) {
        const v4f* xr = (const v4f*)(xin + (size_t)m * D) + lane; v4f v[8];
#pragma unroll
        for (int j = 0; j < 8; ++j) v[j] = xr[64 * j];
        unsigned* xo = (unsigned*)((unsigned char*)XB + (size_t)m * D) + lane;
#pragma unroll
        for (int j = 0; j < 8; ++j) { unsigned w = 0; w = __builtin_amdgcn_cvt_pk_fp8_f32(v[j].x, v[j].y, w, false); w = __builtin_amdgcn_cvt_pk_fp8_f32(v[j].z, v[j].w, w, true); xo[64 * j] = w; }
        float res = 0.f;
#pragma unroll 1
        for (int c = 0; c < 16; ++c) { float a = 0.f;
#pragma unroll
            for (int j = 0; j < 8; ++j) { const v4f w = *(const LAS v4f*)(wsm + c * D + 4 * lane + 256 * j); a += v[j].x * w.x + v[j].y * w.y + v[j].z * w.z + v[j].w * w.w; }
            a = wave_sum(a); if (lane == c) res = a; }
        if (lane < 16) SMALL[(size_t)m * 16 + lane] = res;
    }
    __syncthreads();
}


typedef short bf16x8_t __attribute__((ext_vector_type(8)));
__device__ __forceinline__ void ml_pre_item(const Params& p, int l, LAS unsigned char* lds, int item, int tid, int wave, int lane) {
    const int h = item & 3, n = item >> 2; const size_t t0 = (size_t)n * 64;
    const bf16* Z = (const bf16*)(p.ws + WS_Z); const float* SMALL = (const float*)(p.ws + WS_SMALL);
    bf16* MQ = (bf16*)(p.ws + WS_MQ) + (size_t)item * 4096; bf16* MS = (bf16*)(p.ws + WS_MS) + (size_t)item * 4096; bf16* MK = (bf16*)(p.ws + WS_MK) + (size_t)item * 4096;
    bf16* MV = (bf16*)(p.ws + WS_MV) + (size_t)item * 9216; float* MFL = (float*)(p.ws + WS_MFL);
    LAS float* qs = (LAS float*)lds;
    LAS float* ks = qs + 64 * 65;
    LAS float* bs = ks + 64 * 65;
    LAS unsigned short* vs = (LAS unsigned short*)(bs + 128);
    { const int tk = tid >> 3, c8 = tid & 7; float f[8];
      unpack8(*(const v4u*)(Z + (t0 + tk) * ZC + ZC_MLQ + h * 64 + 8 * c8), f);
#pragma unroll
      for (int i = 0; i < 8; ++i) qs[tk * 65 + 8 * c8 + i] = f[i];
      unpack8(*(const v4u*)(Z + (t0 + tk) * ZC + ZC_MLK + h * 64 + 8 * c8), f);
#pragma unroll
      for (int i = 0; i < 8; ++i) ks[tk * 65 + 8 * c8 + i] = f[i]; }
#pragma unroll
    for (int r = 0; r < 2; ++r) { const int idx = tid + 512 * r, tk = idx >> 4, c8 = idx & 15;
        *(LAS v4u*)(vs + tk * 136 + 8 * c8) = *(const v4u*)(Z + (t0 + tk) * ZC + ZC_MLV + h * 128 + 8 * c8); }
    if (wave == 0) { const float fp = SMALL[(t0 + lane) * 16 + 12 + h] + p.in[I_MLFB][l * 4 + h]; const float lf = -softplusf_(-fp);
        bs[lane] = wave_scan_incl(lf); bs[64 + lane] = SMALL[(t0 + lane) * 16 + 8 + h] + p.in[I_MLIB][l * 4 + h]; }
    __syncthreads();
    const float blast = bs[63];
    { const int i = tid >> 3, jb = tid & 7; const float bi = bs[i];
      { const float e = __expf(bi) * 0.125f; float o[8];
#pragma unroll
        for (int x = 0; x < 8; ++x) o[x] = qs[i * 65 + 8 * jb + x] * e;
        v4u w; w.x = pk2(o[0], o[1]); w.y = pk2(o[2], o[3]); w.z = pk2(o[4], o[5]); w.w = pk2(o[6], o[7]); *(v4u*)(MQ + i * 64 + 8 * jb) = w; }
      { float d[8];
#pragma unroll
        for (int x = 0; x < 8; ++x) d[x] = 0.f;
        if (8 * jb <= i) {
            for (int dd = 0; dd < 64; ++dd) { const float qv = qs[i * 65 + dd];
#pragma unroll
                for (int x = 0; x < 8; ++x) d[x] += qv * ks[(8 * jb + x) * 65 + dd]; }
#pragma unroll
            for (int x = 0; x < 8; ++x) { const int j = 8 * jb + x; d[x] = (j <= i) ? __expf(bi - bs[j] + bs[64 + j]) * d[x] * 0.125f : 0.f; } }
        v4u w; w.x = pk2(d[0], d[1]); w.y = pk2(d[2], d[3]); w.z = pk2(d[4], d[5]); w.w = pk2(d[6], d[7]); *(v4u*)(MS + i * 64 + 8 * jb) = w; }
      { float o[8];
#pragma unroll
        for (int x = 0; x < 8; ++x) { const int j = 8 * jb + x; o[x] = ks[j * 65 + i] * __expf(blast - bs[j] + bs[64 + j]); }
        v4u w; w.x = pk2(o[0], o[1]); w.y = pk2(o[2], o[3]); w.z = pk2(o[4], o[5]); w.w = pk2(o[6], o[7]); *(v4u*)(MK + i * 64 + 8 * jb) = w; }
    }
    { const int c = tid >> 2, jq = tid & 3; unsigned w[8];
#pragma unroll
      for (int x = 0; x < 8; ++x) w[x] = (unsigned)vs[(16 * jq + 2 * x) * 136 + c] | ((unsigned)vs[(16 * jq + 2 * x + 1) * 136 + c] << 16);
      *(v4u*)(MV + c * 64 + 16 * jq) = (v4u){w[0], w[1], w[2], w[3]}; *(v4u*)(MV + c * 64 + 16 * jq + 8) = (v4u){w[4], w[5], w[6], w[7]};
      if (tid < 64) { const int c2 = 128 + (tid >> 2); const unsigned one = (c2 == 128) ? 0x3F803F80u : 0u;
          *(v4u*)(MV + c2 * 64 + 16 * jq) = (v4u){one, one, one, one}; *(v4u*)(MV + c2 * 64 + 16 * jq + 8) = (v4u){one, one, one, one}; } }
    if (tid == 0) MFL[item] = __expf(blast);
    __syncthreads();
}
struct MlFrags { bf16x8_t q[2], s[2], kt[2], vt[2]; float fl; };
__device__ __forceinline__ void ml_load(MlFrags& F, const Params& p, int item, int offA, int offV) {
    const bf16* MQ = (const bf16*)(p.ws + WS_MQ) + (size_t)item * 4096; const bf16* MS = (const bf16*)(p.ws + WS_MS) + (size_t)item * 4096; const bf16* MK = (const bf16*)(p.ws + WS_MK) + (size_t)item * 4096;
    const bf16* MV = (const bf16*)(p.ws + WS_MV) + (size_t)item * 9216;
#pragma unroll
    for (int ks = 0; ks < 2; ++ks) { F.q[ks] = *(const bf16x8_t*)(MQ + offA + 32 * ks); F.s[ks] = *(const bf16x8_t*)(MS + offA + 32 * ks); F.kt[ks] = *(const bf16x8_t*)(MK + offA + 32 * ks); F.vt[ks] = *(const bf16x8_t*)(MV + offV + 32 * ks); }
    F.fl = ((const float*)(p.ws + WS_MFL))[item];
}
__device__ __forceinline__ void ml_seq(const Params& p, LAS unsigned char* lds, int wgi, int wave, int lane) {
    const int u = wgi * 2 + (wave >> 2), wi = wave & 3, h = u / 9, sl = u % 9, g = lane >> 4, c = lane & 15;
    LAS unsigned short* CT = (LAS unsigned short*)(lds + (wave >> 2) * 4096);
    float* HO = (float*)(p.ws + WS_HO); float* HDEN = (float*)(p.ws + WS_HDEN);
    const int offA = (16 * wi + c) * 64 + 8 * g, offV = (16 * sl + c) * 64 + 8 * g;
    *(LAS v2u*)(CT + c * 64 + 16 * wi + 4 * g) = (v2u){0u, 0u};
    pg8::f32x4 Cacc = {0.f, 0.f, 0.f, 0.f};
    __syncthreads();
    MlFrags F0, F1;
    ml_load(F0, p, h, offA, offV);
#define ML_STEP(F, n_) do { const int cur = (n_) & 1; \
        const bf16x8_t c0 = *(const LAS bf16x8_t*)(CT + cur * 1024 + c * 64 + 8 * g), c1 = *(const LAS bf16x8_t*)(CT + cur * 1024 + c * 64 + 32 + 8 * g); \
        pg8::f32x4 num = {0.f, 0.f, 0.f, 0.f}; \
        num = __builtin_amdgcn_mfma_f32_16x16x32_bf16(F.q[0], c0, num, 0, 0, 0); num = __builtin_amdgcn_mfma_f32_16x16x32_bf16(F.q[1], c1, num, 0, 0, 0); \
        num = __builtin_amdgcn_mfma_f32_16x16x32_bf16(F.s[0], F.vt[0], num, 0, 0, 0); num = __builtin_amdgcn_mfma_f32_16x16x32_bf16(F.s[1], F.vt[1], num, 0, 0, 0); \
        Cacc = Cacc * F.fl; \
        Cacc = __builtin_amdgcn_mfma_f32_16x16x32_bf16(F.kt[0], F.vt[0], Cacc, 0, 0, 0); Cacc = __builtin_amdgcn_mfma_f32_16x16x32_bf16(F.kt[1], F.vt[1], Cacc, 0, 0, 0); \
        { v2u w; w.x = pk2(Cacc[0], Cacc[1]); w.y = pk2(Cacc[2], Cacc[3]); *(LAS v2u*)(CT + (cur ^ 1) * 1024 + c * 64 + 16 * wi + 4 * g) = w; } \
        { const size_t tb = (size_t)(n_) * 64 + 16 * wi + 4 * g; \
          if (sl < 8) { _Pragma("unroll") for (int r = 0; r < 4; ++r) HO[(tb + r) * BW + h * 128 + 16 * sl + c] = num[r]; } \
          else if (c == 0) { _Pragma("unroll") for (int r = 0; r < 4; ++r) HDEN[(tb + r) * 4 + h] = num[r]; } } \
        LDS_BAR(); } while (0)
    for (int n = 0; n < T / 64; n += 2) {
        ml_load(F1, p, (n + 1) * 4 + h, offA, offV);
        ML_STEP(F0, n);
        ml_load(F0, p, ((n + 2 < T / 64) ? n + 2 : n) * 4 + h, offA, offV);
        ML_STEP(F1, n + 1);
    }
#undef ML_STEP
}


constexpr int QP = 132;
__device__ __forceinline__ void gdn_pre_item(const Params& p, int l, LAS unsigned char* lds, int item, int tid, int wave, int lane) {
    const int h = item & 3, n = item >> 2; const size_t t0 = (size_t)n * 64;
    const bf16* Z = (const bf16*)(p.ws + WS_Z); const float* SMALL = (const float*)(p.ws + WS_SMALL);
    float* GU = (float*)(p.ws + WS_GU) + (size_t)item * 8192; bf16* GNW = (bf16*)(p.ws + WS_GNW) + (size_t)item * 8192; bf16* GQG = (bf16*)(p.ws + WS_GQG) + (size_t)item * 8192;
    bf16* GAT = (bf16*)(p.ws + WS_GAT) + (size_t)item * 4096; bf16* GKT = (bf16*)(p.ws + WS_GKT) + (size_t)item * 8192; float* GDL = (float*)(p.ws + WS_GDL);
    const float* cw = p.in[I_CONVW] + (size_t)l * 4 * 1536;
    LAS float* qs = (LAS float*)lds; LAS float* ks = qs + 64 * QP; LAS float* vs = ks + 64 * QP; LAS float* Ls = vs + 64 * QP;   LAS float* gcs = Ls + 64 * 68; LAS float* bts = gcs + 64; LAS float* btg = bts + 64;
    { const int tk = tid >> 3, part = tid & 7;
#pragma unroll 1
      for (int i = 0; i < 3; ++i) { float a[16];
#pragma unroll
        for (int x = 0; x < 16; ++x) a[x] = 0.f;
#pragma unroll
        for (int j = 0; j < 4; ++j) { const long tt = (long)t0 + tk - 3 + j; if (tt >= 0) {
            const bf16* src = Z + (size_t)tt * ZC + ZC_GDN + i * 512 + h * 128 + 16 * part; float x0[8], x1[8]; unpack8(*(const v4u*)src, x0); unpack8(*(const v4u*)(src + 8), x1);
            const float* wp = cw + j * 1536 + i * 512 + h * 128 + 16 * part;
#pragma unroll
            for (int x = 0; x < 8; ++x) { a[x] += wp[x] * x0[x]; a[8 + x] += wp[8 + x] * x1[x]; } } }
        float ss = 0.f;
#pragma unroll
        for (int x = 0; x < 16; ++x) { a[x] = siluf_(a[x]); ss += a[x] * a[x]; }
        if (i < 2) { ss = sum8(ss); const float r = rsqrtf(ss + 1e-6f) * (i == 0 ? 0.08838834764831845f : 1.f);
#pragma unroll
            for (int x = 0; x < 16; ++x) a[x] *= r; }
        LAS float* dst = (i == 0 ? qs : (i == 1 ? ks : vs)) + tk * QP + 16 * part;
#pragma unroll
        for (int x4 = 0; x4 < 4; ++x4) *(LAS v4f*)(dst + 4 * x4) = (v4f){a[4 * x4], a[4 * x4 + 1], a[4 * x4 + 2], a[4 * x4 + 3]}; } }
    if (wave == 0) { const float bb = SMALL[(t0 + lane) * 16 + h], aa = SMALL[(t0 + lane) * 16 + 4 + h];
        const float g = -__expf(p.in[I_ALOG][l * 4 + h]) * softplusf_(aa + p.in[I_DTB][l * 4 + h]);
        const float gc = wave_scan_incl(g), bt = sigmoidf_(bb); gcs[lane] = gc; bts[lane] = bt; btg[lane] = bt * __expf(gc); }
    __syncthreads();
    { const int i = tid >> 3, jb = tid & 7; const float gi = gcs[i], bi = bts[i]; float dk[8], dq[8];
#pragma unroll
      for (int x = 0; x < 8; ++x) { dk[x] = 0.f; dq[x] = 0.f; }
      if (8 * jb <= i) {
#pragma unroll 2
          for (int d4 = 0; d4 < 32; ++d4) { const v4f qi = *(const LAS v4f*)(qs + i * QP + 4 * d4), ki = *(const LAS v4f*)(ks + i * QP + 4 * d4);
#pragma unroll
              for (int x = 0; x < 8; ++x) { const v4f kj = *(const LAS v4f*)(ks + (8 * jb + x) * QP + 4 * d4);
                  dk[x] += ki.x * kj.x + ki.y * kj.y + ki.z * kj.z + ki.w * kj.w; dq[x] += qi.x * kj.x + qi.y * kj.y + qi.z * kj.z + qi.w * kj.w; } }
#pragma unroll
          for (int x = 0; x < 8; ++x) { const int j = 8 * jb + x; const float dc = __expf(gi - gcs[j]); dk[x] = (j < i) ? bi * dk[x] * dc : 0.f; dq[x] = (j <= i) ? dq[x] * dc : 0.f; } }
      *(LAS v4f*)(Ls + i * 68 + 8 * jb) = (v4f){dk[0], dk[1], dk[2], dk[3]}; *(LAS v4f*)(Ls + i * 68 + 8 * jb + 4) = (v4f){dk[4], dk[5], dk[6], dk[7]};
      v4u w; w.x = pk2(dq[0], dq[1]); w.y = pk2(dq[2], dq[3]); w.z = pk2(dq[4], dq[5]); w.w = pk2(dq[6], dq[7]); *(v4u*)(GAT + i * 64 + 8 * jb) = w; }
    __syncthreads();
    if (tid < 256) {
        const int c = tid; int vz; asm volatile("v_mov_b32 %0, 0" : "=v"(vz));
        const LAS float* rp = (c < 128) ? (vs + c) : (ks + (c - 128)); const LAS float* mp = ((c < 128) ? bts : btg) + vz;
#define GDN_RHS(i) (rp[(i) * QP] * mp[(i)])
#define GDN_L4(i, j4) (*(const LAS v4f*)(Ls + (i) * 68 + 4 * (j4) + vz))
        float x0 = GDN_RHS(0); __builtin_amdgcn_sched_barrier(0);
        float x1 = GDN_RHS(1); { const v4f l = GDN_L4(1, 0); x1 -= l.x * x0; } __builtin_amdgcn_sched_barrier(0);
        float x2 = GDN_RHS(2); { const v4f l = GDN_L4(2, 0); x2 -= l.x * x0; x2 -= l.y * x1; } __builtin_amdgcn_sched_barrier(0);
        float x3 = GDN_RHS(3); { const v4f l = GDN_L4(3, 0); x3 -= l.x * x0; x3 -= l.y * x1; x3 -= l.z * x2; } __builtin_amdgcn_sched_barrier(0);
        float x4 = GDN_RHS(4); { const v4f l = GDN_L4(4, 0); x4 -= l.x * x0; x4 -= l.y * x1; x4 -= l.z * x2; x4 -= l.w * x3; } __builtin_amdgcn_sched_barrier(0);
        float x5 = GDN_RHS(5); { const v4f l = GDN_L4(5, 0); x5 -= l.x * x0; x5 -= l.y * x1; x5 -= l.z * x2; x5 -= l.w * x3; } { const v4f l = GDN_L4(5, 1); x5 -= l.x * x4; } __builtin_amdgcn_sched_barrier(0);
        float x6 = GDN_RHS(6); { const v4f l = GDN_L4(6, 0); x6 -= l.x * x0; x6 -= l.y * x1; x6 -= l.z * x2; x6 -= l.w * x3; } { const v4f l = GDN_L4(6, 1); x6 -= l.x * x4; x6 -= l.y * x5; } __builtin_amdgcn_sched_barrier(0);
        float x7 = GDN_RHS(7); { const v4f l = GDN_L4(7, 0); x7 -= l.x * x0; x7 -= l.y * x1; x7 -= l.z * x2; x7 -= l.w * x3; } { const v4f l = GDN_L4(7, 1); x7 -= l.x * x4; x7 -= l.y * x5; x7 -= l.z * x6; } __builtin_amdgcn_sched_barrier(0);
        float x8 = GDN_RHS(8); { const v4f l = GDN_L4(8, 0); x8 -= l.x * x0; x8 -= l.y * x1; x8 -= l.z * x2; x8 -= l.w * x3; } { const v4f l = GDN_L4(8, 1); x8 -= l.x * x4; x8 -= l.y * x5; x8 -= l.z * x6; x8 -= l.w * x7; } __builtin_amdgcn_sched_barrier(0);
        float x9 = GDN_RHS(9); { const v4f l = GDN_L4(9, 0); x9 -= l.x * x0; x9 -= l.y * x1; x9 -= l.z * x2; x9 -= l.w * x3; } { const v4f l = GDN_L4(9, 1); x9 -= l.x * x4; x9 -= l.y * x5; x9 -= l.z * x6; x9 -= l.w * x7; } { const v4f l = GDN_L4(9, 2); x9 -= l.x * x8; } __builtin_amdgcn_sched_barrier(0);
        float x10 = GDN_RHS(10); { const v4f l = GDN_L4(10, 0); x10 -= l.x * x0; x10 -= l.y * x1; x10 -= l.z * x2; x10 -= l.w * x3; } { const v4f l = GDN_L4(10, 1); x10 -= l.x * x4; x10 -= l.y * x5; x10 -= l.z * x6; x10 -= l.w * x7; } { const v4f l = GDN_L4(10, 2); x10 -= l.x * x8; x10 -= l.y * x9; } __builtin_amdgcn_sched_barrier(0);
        float x11 = GDN_RHS(11); { const v4f l = GDN_L4(11, 0); x11 -= l.x * x0; x11 -= l.y * x1; x11 -= l.z * x2; x11 -= l.w * x3; } { const v4f l = GDN_L4(11, 1); x11 -= l.x * x4; x11 -= l.y * x5; x11 -= l.z * x6; x11 -= l.w * x7; } { const v4f l = GDN_L4(11, 2); x11 -= l.x * x8; x11 -= l.y * x9; x11 -= l.z * x10; } __builtin_amdgcn_sched_barrier(0);
        float x12 = GDN_RHS(12); { const v4f l = GDN_L4(12, 0); x12 -= l.x * x0; x12 -= l.y * x1; x12 -= l.z * x2; x12 -= l.w * x3; } { const v4f l = GDN_L4(12, 1); x12 -= l.x * x4; x12 -= l.y * x5; x12 -= l.z * x6; x12 -= l.w * x7; } { const v4f l = GDN_L4(12, 2); x12 -= l.x * x8; x12 -= l.y * x9; x12 -= l.z * x10; x12 -= l.w * x11; } __builtin_amdgcn_sched_barrier(0);
        float x13 = GDN_RHS(13); { const v4f l = GDN_L4(13, 0); x13 -= l.x * x0; x13 -= l.y * x1; x13 -= l.z * x2; x13 -= l.w * x3; } { const v4f l = GDN_L4(13, 1); x13 -= l.x * x4; x13 -= l.y * x5; x13 -= l.z * x6; x13 -= l.w * x7; } { const v4f l = GDN_L4(13, 2); x13 -= l.x * x8; x13 -= l.y * x9; x13 -= l.z * x10; x13 -= l.w * x11; } { const v4f l = GDN_L4(13, 3); x13 -= l.x * x12; } __builtin_amdgcn_sched_barrier(0);
        float x14 = GDN_RHS(14); { const v4f l = GDN_L4(14, 0); x14 -= l.x * x0; x14 -= l.y * x1; x14 -= l.z * x2; x14 -= l.w * x3; } { const v4f l = GDN_L4(14, 1); x14 -= l.x * x4; x14 -= l.y * x5; x14 -= l.z * x6; x14 -= l.w * x7; } { const v4f l = GDN_L4(14, 2); x14 -= l.x * x8; x14 -= l.y * x9; x14 -= l.z * x10; x14 -= l.w * x11; } { const v4f l = GDN_L4(14, 3); x14 -= l.x * x12; x14 -= l.y * x13; } __builtin_amdgcn_sched_barrier(0);
        float x15 = GDN_RHS(15); { const v4f l = GDN_L4(15, 0); x15 -= l.x * x0; x15 -= l.y * x1; x15 -= l.z * x2; x15 -= l.w * x3; } { const v4f l = GDN_L4(15, 1); x15 -= l.x * x4; x15 -= l.y * x5; x15 -= l.z * x6; x15 -= l.w * x7; } { const v4f l = GDN_L4(15, 2); x15 -= l.x * x8; x15 -= l.y * x9; x15 -= l.z * x10; x15 -= l.w * x11; } { const v4f l = GDN_L4(15, 3); x15 -= l.x * x12; x15 -= l.y * x13; x15 -= l.z * x14; } __builtin_amdgcn_sched_barrier(0);
        float x16 = GDN_RHS(16); { const v4f l = GDN_L4(16, 0); x16 -= l.x * x0; x16 -= l.y * x1; x16 -= l.z * x2; x16 -= l.w * x3; } { const v4f l = GDN_L4(16, 1); x16 -= l.x * x4; x16 -= l.y * x5; x16 -= l.z * x6; x16 -= l.w * x7; } { const v4f l = GDN_L4(16, 2); x16 -= l.x * x8; x16 -= l.y * x9; x16 -= l.z * x10; x16 -= l.w * x11; } { const v4f l = GDN_L4(16, 3); x16 -= l.x * x12; x16 -= l.y * x13; x16 -= l.z * x14; x16 -= l.w * x15; } __builtin_amdgcn_sched_barrier(0);
        float x17 = GDN_RHS(17); { const v4f l = GDN_L4(17, 0); x17 -= l.x * x0; x17 -= l.y * x1; x17 -= l.z * x2; x17 -= l.w * x3; } { const v4f l = GDN_L4(17, 1); x17 -= l.x * x4; x17 -= l.y * x5; x17 -= l.z * x6; x17 -= l.w * x7; } { const v4f l = GDN_L4(17, 2); x17 -= l.x * x8; x17 -= l.y * x9; x17 -= l.z * x10; x17 -= l.w * x11; } { const v4f l = GDN_L4(17, 3); x17 -= l.x * x12; x17 -= l.y * x13; x17 -= l.z * x14; x17 -= l.w * x15; } { const v4f l = GDN_L4(17, 4); x17 -= l.x * x16; } __builtin_amdgcn_sched_barrier(0);
        float x18 = GDN_RHS(18); { const v4f l = GDN_L4(18, 0); x18 -= l.x * x0; x18 -= l.y * x1; x18 -= l.z * x2; x18 -= l.w * x3; } { const v4f l = GDN_L4(18, 1); x18 -= l.x * x4; x18 -= l.y * x5; x18 -= l.z * x6; x18 -= l.w * x7; } { const v4f l = GDN_L4(18, 2); x18 -= l.x * x8; x18 -= l.y * x9; x18 -= l.z * x10; x18 -= l.w * x11; } { const v4f l = GDN_L4(18, 3); x18 -= l.x * x12; x18 -= l.y * x13; x18 -= l.z * x14; x18 -= l.w * x15; } { const v4f l = GDN_L4(18, 4); x18 -= l.x * x16; x18 -= l.y * x17; } __builtin_amdgcn_sched_barrier(0);
        float x19 = GDN_RHS(19); { const v4f l = GDN_L4(19, 0); x19 -= l.x * x0; x19 -= l.y * x1; x19 -= l.z * x2; x19 -= l.w * x3; } { const v4f l = GDN_L4(19, 1); x19 -= l.x * x4; x19 -= l.y * x5; x19 -= l.z * x6; x19 -= l.w * x7; } { const v4f l = GDN_L4(19, 2); x19 -= l.x * x8; x19 -= l.y * x9; x19 -= l.z * x10; x19 -= l.w * x11; } { const v4f l = GDN_L4(19, 3); x19 -= l.x * x12; x19 -= l.y * x13; x19 -= l.z * x14; x19 -= l.w * x15; } { const v4f l = GDN_L4(19, 4); x19 -= l.x * x16; x19 -= l.y * x17; x19 -= l.z * x18; } __builtin_amdgcn_sched_barrier(0);
        float x20 = GDN_RHS(20); { const v4f l = GDN_L4(20, 0); x20 -= l.x * x0; x20 -= l.y * x1; x20 -= l.z * x2; x20 -= l.w * x3; } { const v4f l = GDN_L4(20, 1); x20 -= l.x * x4; x20 -= l.y * x5; x20 -= l.z * x6; x20 -= l.w * x7; } { const v4f l = GDN_L4(20, 2); x20 -= l.x * x8; x20 -= l.y * x9; x20 -= l.z * x10; x20 -= l.w * x11; } { const v4f l = GDN_L4(20, 3); x20 -= l.x * x12; x20 -= l.y * x13; x20 -= l.z * x14; x20 -= l.w * x15; } { const v4f l = GDN_L4(20, 4); x20 -= l.x * x16; x20 -= l.y * x17; x20 -= l.z * x18; x20 -= l.w * x19; } __builtin_amdgcn_sched_barrier(0);
        float x21 = GDN_RHS(21); { const v4f l = GDN_L4(21, 0); x21 -= l.x * x0; x21 -= l.y * x1; x21 -= l.z * x2; x21 -= l.w * x3; } { const v4f l = GDN_L4(21, 1); x21 -= l.x * x4; x21 -= l.y * x5; x21 -= l.z * x6; x21 -= l.w * x7; } { const v4f l = GDN_L4(21, 2); x21 -= l.x * x8; x21 -= l.y * x9; x21 -= l.z * x10; x21 -= l.w * x11; } { const v4f l = GDN_L4(21, 3); x21 -= l.x * x12; x21 -= l.y * x13; x21 -= l.z * x14; x21 -= l.w * x15; } { const v4f l = GDN_L4(21, 4); x21 -= l.x * x16; x21 -= l.y * x17; x21 -= l.z * x18; x21 -= l.w * x19; } { const v4f l = GDN_L4(21, 5); x21 -= l.x * x20; } __builtin_amdgcn_sched_barrier(0);
        float x22 = GDN_RHS(22); { const v4f l = GDN_L4(22, 0); x22 -= l.x * x0; x22 -= l.y * x1; x22 -= l.z * x2; x22 -= l.w * x3; } { const v4f l = GDN_L4(22, 1); x22 -= l.x * x4; x22 -= l.y * x5; x22 -= l.z * x6; x22 -= l.w * x7; } { const v4f l = GDN_L4(22, 2); x22 -= l.x * x8; x22 -= l.y * x9; x22 -= l.z * x10; x22 -= l.w * x11; } { const v4f l = GDN_L4(22, 3); x22 -= l.x * x12; x22 -= l.y * x13; x22 -= l.z * x14; x22 -= l.w * x15; } { const v4f l = GDN_L4(22, 4); x22 -= l.x * x16; x22 -= l.y * x17; x22 -= l.z * x18; x22 -= l.w * x19; } { const v4f l = GDN_L4(22, 5); x22 -= l.x * x20; x22 -= l.y * x21; } __builtin_amdgcn_sched_barrier(0);
        float x23 = GDN_RHS(23); { const v4f l = GDN_L4(23, 0); x23 -= l.x * x0; x23 -= l.y * x1; x23 -= l.z * x2; x23 -= l.w * x3; } { const v4f l = GDN_L4(23, 1); x23 -= l.x * x4; x23 -= l.y * x5; x23 -= l.z * x6; x23 -= l.w * x7; } { const v4f l = GDN_L4(23, 2); x23 -= l.x * x8; x23 -= l.y * x9; x23 -= l.z * x10; x23 -= l.w * x11; } { const v4f l = GDN_L4(23, 3); x23 -= l.x * x12; x23 -= l.y * x13; x23 -= l.z * x14; x23 -= l.w * x15; } { const v4f l = GDN_L4(23, 4); x23 -= l.x * x16; x23 -= l.y * x17; x23 -= l.z * x18; x23 -= l.w * x19; } { const v4f l = GDN_L4(23, 5); x23 -= l.x * x20; x23 -= l.y * x21; x23 -= l.z * x22; } __builtin_amdgcn_sched_barrier(0);
        float x24 = GDN_RHS(24); { const v4f l = GDN_L4(24, 0); x24 -= l.x * x0; x24 -= l.y * x1; x24 -= l.z * x2; x24 -= l.w * x3; } { const v4f l = GDN_L4(24, 1); x24 -= l.x * x4; x24 -= l.y * x5; x24 -= l.z * x6; x24 -= l.w * x7; } { const v4f l = GDN_L4(24, 2); x24 -= l.x * x8; x24 -= l.y * x9; x24 -= l.z * x10; x24 -= l.w * x11; } { const v4f l = GDN_L4(24, 3); x24 -= l.x * x12; x24 -= l.y * x13; x24 -= l.z * x14; x24 -= l.w * x15; } { const v4f l = GDN_L4(24, 4); x24 -= l.x * x16; x24 -= l.y * x17; x24 -= l.z * x18; x24 -= l.w * x19; } { const v4f l = GDN_L4(24, 5); x24 -= l.x * x20; x24 -= l.y * x21; x24 -= l.z * x22; x24 -= l.w * x23; } __builtin_amdgcn_sched_barrier(0);
        float x25 = GDN_RHS(25); { const v4f l = GDN_L4(25, 0); x25 -= l.x * x0; x25 -= l.y * x1; x25 -= l.z * x2; x25 -= l.w * x3; } { const v4f l = GDN_L4(25, 1); x25 -= l.x * x4; x25 -= l.y * x5; x25 -= l.z * x6; x25 -= l.w * x7; } { const v4f l = GDN_L4(25, 2); x25 -= l.x * x8; x25 -= l.y * x9; x25 -= l.z * x10; x25 -= l.w * x11; } { const v4f l = GDN_L4(25, 3); x25 -= l.x * x12; x25 -= l.y * x13; x25 -= l.z * x14; x25 -= l.w * x15; } { const v4f l = GDN_L4(25, 4); x25 -= l.x * x16; x25 -= l.y * x17; x25 -= l.z * x18; x25 -= l.w * x19; } { const v4f l = GDN_L4(25, 5); x25 -= l.x * x20; x25 -= l.y * x21; x25 -= l.z * x22; x25 -= l.w * x23; } { const v4f l = GDN_L4(25, 6); x25 -= l.x * x24; } __builtin_amdgcn_sched_barrier(0);
        float x26 = GDN_RHS(26); { const v4f l = GDN_L4(26, 0); x26 -= l.x * x0; x26 -= l.y * x1; x26 -= l.z * x2; x26 -= l.w * x3; } { const v4f l = GDN_L4(26, 1); x26 -= l.x * x4; x26 -= l.y * x5; x26 -= l.z * x6; x26 -= l.w * x7; } { const v4f l = GDN_L4(26, 2); x26 -= l.x * x8; x26 -= l.y * x9; x26 -= l.z * x10; x26 -= l.w * x11; } { const v4f l = GDN_L4(26, 3); x26 -= l.x * x12; x26 -= l.y * x13; x26 -= l.z * x14; x26 -= l.w * x15; } { const v4f l = GDN_L4(26, 4); x26 -= l.x * x16; x26 -= l.y * x17; x26 -= l.z * x18; x26 -= l.w * x19; } { const v4f l = GDN_L4(26, 5); x26 -= l.x * x20; x26 -= l.y * x21; x26 -= l.z * x22; x26 -= l.w * x23; } { const v4f l = GDN_L4(26, 6); x26 -= l.x * x24; x26 -= l.y * x25; } __builtin_amdgcn_sched_barrier(0);
        float x27 = GDN_RHS(27); { const v4f l = GDN_L4(27, 0); x27 -= l.x * x0; x27 -= l.y * x1; x27 -= l.z * x2; x27 -= l.w * x3; } { const v4f l = GDN_L4(27, 1); x27 -= l.x * x4; x27 -= l.y * x5; x27 -= l.z * x6; x27 -= l.w * x7; } { const v4f l = GDN_L4(27, 2); x27 -= l.x * x8; x27 -= l.y * x9; x27 -= l.z * x10; x27 -= l.w * x11; } { const v4f l = GDN_L4(27, 3); x27 -= l.x * x12; x27 -= l.y * x13; x27 -= l.z * x14; x27 -= l.w * x15; } { const v4f l = GDN_L4(27, 4); x27 -= l.x * x16; x27 -= l.y * x17; x27 -= l.z * x18; x27 -= l.w * x19; } { const v4f l = GDN_L4(27, 5); x27 -= l.x * x20; x27 -= l.y * x21; x27 -= l.z * x22; x27 -= l.w * x23; } { const v4f l = GDN_L4(27, 6); x27 -= l.x * x24; x27 -= l.y * x25; x27 -= l.z * x26; } __builtin_amdgcn_sched_barrier(0);
        float x28 = GDN_RHS(28); { const v4f l = GDN_L4(28, 0); x28 -= l.x * x0; x28 -= l.y * x1; x28 -= l.z * x2; x28 -= l.w * x3; } { const v4f l = GDN_L4(28, 1); x28 -= l.x * x4; x28 -= l.y * x5; x28 -= l.z * x6; x28 -= l.w * x7; } { const v4f l = GDN_L4(28, 2); x28 -= l.x * x8; x28 -= l.y * x9; x28 -= l.z * x10; x28 -= l.w * x11; } { const v4f l = GDN_L4(28, 3); x28 -= l.x * x12; x28 -= l.y * x13; x28 -= l.z * x14; x28 -= l.w * x15; } { const v4f l = GDN_L4(28, 4); x28 -= l.x * x16; x28 -= l.y * x17; x28 -= l.z * x18; x28 -= l.w * x19; } { const v4f l = GDN_L4(28, 5); x28 -= l.x * x20; x28 -= l.y * x21; x28 -= l.z * x22; x28 -= l.w * x23; } { const v4f l = GDN_L4(28, 6); x28 -= l.x * x24; x28 -= l.y * x25; x28 -= l.z * x26; x28 -= l.w * x27; } __builtin_amdgcn_sched_barrier(0);
        float x29 = GDN_RHS(29); { const v4f l = GDN_L4(29, 0); x29 -= l.x * x0; x29 -= l.y * x1; x29 -= l.z * x2; x29 -= l.w * x3; } { const v4f l = GDN_L4(29, 1); x29 -= l.x * x4; x29 -= l.y * x5; x29 -= l.z * x6; x29 -= l.w * x7; } { const v4f l = GDN_L4(29, 2); x29 -= l.x * x8; x29 -= l.y * x9; x29 -= l.z * x10; x29 -= l.w * x11; } { const v4f l = GDN_L4(29, 3); x29 -= l.x * x12; x29 -= l.y * x13; x29 -= l.z * x14; x29 -= l.w * x15; } { const v4f l = GDN_L4(29, 4); x29 -= l.x * x16; x29 -= l.y * x17; x29 -= l.z * x18; x29 -= l.w * x19; } { const v4f l = GDN_L4(29, 5); x29 -= l.x * x20; x29 -= l.y * x21; x29 -= l.z * x22; x29 -= l.w * x23; } { const v4f l = GDN_L4(29, 6); x29 -= l.x * x24; x29 -= l.y * x25; x29 -= l.z * x26; x29 -= l.w * x27; } { const v4f l = GDN_L4(29, 7); x29 -= l.x * x28; } __builtin_amdgcn_sched_barrier(0);
        float x30 = GDN_RHS(30); { const v4f l = GDN_L4(30, 0); x30 -= l.x * x0; x30 -= l.y * x1; x30 -= l.z * x2; x30 -= l.w * x3; } { const v4f l = GDN_L4(30, 1); x30 -= l.x * x4; x30 -= l.y * x5; x30 -= l.z * x6; x30 -= l.w * x7; } { const v4f l = GDN_L4(30, 2); x30 -= l.x * x8; x30 -= l.y * x9; x30 -= l.z * x10; x30 -= l.w * x11; } { const v4f l = GDN_L4(30, 3); x30 -= l.x * x12; x30 -= l.y * x13; x30 -= l.z * x14; x30 -= l.w * x15; } { const v4f l = GDN_L4(30, 4); x30 -= l.x * x16; x30 -= l.y * x17; x30 -= l.z * x18; x30 -= l.w * x19; } { const v4f l = GDN_L4(30, 5); x30 -= l.x * x20; x30 -= l.y * x21; x30 -= l.z * x22; x30 -= l.w * x23; } { const v4f l = GDN_L4(30, 6); x30 -= l.x * x24; x30 -= l.y * x25; x30 -= l.z * x26; x30 -= l.w * x27; } { const v4f l = GDN_L4(30, 7); x30 -= l.x * x28; x30 -= l.y * x29; } __builtin_amdgcn_sched_barrier(0);
        float x31 = GDN_RHS(31); { const v4f l = GDN_L4(31, 0); x31 -= l.x * x0; x31 -= l.y * x1; x31 -= l.z * x2; x31 -= l.w * x3; } { const v4f l = GDN_L4(31, 1); x31 -= l.x * x4; x31 -= l.y * x5; x31 -= l.z * x6; x31 -= l.w * x7; } { const v4f l = GDN_L4(31, 2); x31 -= l.x * x8; x31 -= l.y * x9; x31 -= l.z * x10; x31 -= l.w * x11; } { const v4f l = GDN_L4(31, 3); x31 -= l.x * x12; x31 -= l.y * x13; x31 -= l.z * x14; x31 -= l.w * x15; } { const v4f l = GDN_L4(31, 4); x31 -= l.x * x16; x31 -= l.y * x17; x31 -= l.z * x18; x31 -= l.w * x19; } { const v4f l = GDN_L4(31, 5); x31 -= l.x * x20; x31 -= l.y * x21; x31 -= l.z * x22; x31 -= l.w * x23; } { const v4f l = GDN_L4(31, 6); x31 -= l.x * x24; x31 -= l.y * x25; x31 -= l.z * x26; x31 -= l.w * x27; } { const v4f l = GDN_L4(31, 7); x31 -= l.x * x28; x31 -= l.y * x29; x31 -= l.z * x30; } __builtin_amdgcn_sched_barrier(0);
        float x32 = GDN_RHS(32); { const v4f l = GDN_L4(32, 0); x32 -= l.x * x0; x32 -= l.y * x1; x32 -= l.z * x2; x32 -= l.w * x3; } { const v4f l = GDN_L4(32, 1); x32 -= l.x * x4; x32 -= l.y * x5; x32 -= l.z * x6; x32 -= l.w * x7; } { const v4f l = GDN_L4(32, 2); x32 -= l.x * x8; x32 -= l.y * x9; x32 -= l.z * x10; x32 -= l.w * x11; } { const v4f l = GDN_L4(32, 3); x32 -= l.x * x12; x32 -= l.y * x13; x32 -= l.z * x14; x32 -= l.w * x15; } { const v4f l = GDN_L4(32, 4); x32 -= l.x * x16; x32 -= l.y * x17; x32 -= l.z * x18; x32 -= l.w * x19; } { const v4f l = GDN_L4(32, 5); x32 -= l.x * x20; x32 -= l.y * x21; x32 -= l.z * x22; x32 -= l.w * x23; } { const v4f l = GDN_L4(32, 6); x32 -= l.x * x24; x32 -= l.y * x25; x32 -= l.z * x26; x32 -= l.w * x27; } { const v4f l = GDN_L4(32, 7); x32 -= l.x * x28; x32 -= l.y * x29; x32 -= l.z * x30; x32 -= l.w * x31; } __builtin_amdgcn_sched_barrier(0);
        float x33 = GDN_RHS(33); { const v4f l = GDN_L4(33, 0); x33 -= l.x * x0; x33 -= l.y * x1; x33 -= l.z * x2; x33 -= l.w * x3; } { const v4f l = GDN_L4(33, 1); x33 -= l.x * x4; x33 -= l.y * x5; x33 -= l.z * x6; x33 -= l.w * x7; } { const v4f l = GDN_L4(33, 2); x33 -= l.x * x8; x33 -= l.y * x9; x33 -= l.z * x10; x33 -= l.w * x11; } { const v4f l = GDN_L4(33, 3); x33 -= l.x * x12; x33 -= l.y * x13; x33 -= l.z * x14; x33 -= l.w * x15; } { const v4f l = GDN_L4(33, 4); x33 -= l.x * x16; x33 -= l.y * x17; x33 -= l.z * x18; x33 -= l.w * x19; } { const v4f l = GDN_L4(33, 5); x33 -= l.x * x20; x33 -= l.y * x21; x33 -= l.z * x22; x33 -= l.w * x23; } { const v4f l = GDN_L4(33, 6); x33 -= l.x * x24; x33 -= l.y * x25; x33 -= l.z * x26; x33 -= l.w * x27; } { const v4f l = GDN_L4(33, 7); x33 -= l.x * x28; x33 -= l.y * x29; x33 -= l.z * x30; x33 -= l.w * x31; } { const v4f l = GDN_L4(33, 8); x33 -= l.x * x32; } __builtin_amdgcn_sched_barrier(0);
        float x34 = GDN_RHS(34); { const v4f l = GDN_L4(34, 0); x34 -= l.x * x0; x34 -= l.y * x1; x34 -= l.z * x2; x34 -= l.w * x3; } { const v4f l = GDN_L4(34, 1); x34 -= l.x * x4; x34 -= l.y * x5; x34 -= l.z * x6; x34 -= l.w * x7; } { const v4f l = GDN_L4(34, 2); x34 -= l.x * x8; x34 -= l.y * x9; x34 -= l.z * x10; x34 -= l.w * x11; } { const v4f l = GDN_L4(34, 3); x34 -= l.x * x12; x34 -= l.y * x13; x34 -= l.z * x14; x34 -= l.w * x15; } { const v4f l = GDN_L4(34, 4); x34 -= l.x * x16; x34 -= l.y * x17; x34 -= l.z * x18; x34 -= l.w * x19; } { const v4f l = GDN_L4(34, 5); x34 -= l.x * x20; x34 -= l.y * x21; x34 -= l.z * x22; x34 -= l.w * x23; } { const v4f l = GDN_L4(34, 6); x34 -= l.x * x24; x34 -= l.y * x25; x34 -= l.z * x26; x34 -= l.w * x27; } { const v4f l = GDN_L4(34, 7); x34 -= l.x * x28; x34 -= l.y * x29; x34 -= l.z * x30; x34 -= l.w * x31; } { const v4f l = GDN_L4(34, 8); x34 -= l.x * x32; x34 -= l.y * x33; } __builtin_amdgcn_sched_barrier(0);
        float x35 = GDN_RHS(35); { const v4f l = GDN_L4(35, 0); x35 -= l.x * x0; x35 -= l.y * x1; x35 -= l.z * x2; x35 -= l.w * x3; } { const v4f l = GDN_L4(35, 1); x35 -= l.x * x4; x35 -= l.y * x5; x35 -= l.z * x6; x35 -= l.w * x7; } { const v4f l = GDN_L4(35, 2); x35 -= l.x * x8; x35 -= l.y * x9; x35 -= l.z * x10; x35 -= l.w * x11; } { const v4f l = GDN_L4(35, 3); x35 -= l.x * x12; x35 -= l.y * x13; x35 -= l.z * x14; x35 -= l.w * x15; } { const v4f l = GDN_L4(35, 4); x35 -= l.x * x16; x35 -= l.y * x17; x35 -= l.z * x18; x35 -= l.w * x19; } { const v4f l = GDN_L4(35, 5); x35 -= l.x * x20; x35 -= l.y * x21; x35 -= l.z * x22; x35 -= l.w * x23; } { const v4f l = GDN_L4(35, 6); x35 -= l.x * x24; x35 -= l.y * x25; x35 -= l.z * x26; x35 -= l.w * x27; } { const v4f l = GDN_L4(35, 7); x35 -= l.x * x28; x35 -= l.y * x29; x35 -= l.z * x30; x35 -= l.w * x31; } { const v4f l = GDN_L4(35, 8); x35 -= l.x * x32; x35 -= l.y * x33; x35 -= l.z * x34; } __builtin_amdgcn_sched_barrier(0);
        float x36 = GDN_RHS(36); { const v4f l = GDN_L4(36, 0); x36 -= l.x * x0; x36 -= l.y * x1; x36 -= l.z * x2; x36 -= l.w * x3; } { const v4f l = GDN_L4(36, 1); x36 -= l.x * x4; x36 -= l.y * x5; x36 -= l.z * x6; x36 -= l.w * x7; } { const v4f l = GDN_L4(36, 2); x36 -= l.x * x8; x36 -= l.y * x9; x36 -= l.z * x10; x36 -= l.w * x11; } { const v4f l = GDN_L4(36, 3); x36 -= l.x * x12; x36 -= l.y * x13; x36 -= l.z * x14; x36 -= l.w * x15; } { const v4f l = GDN_L4(36, 4); x36 -= l.x * x16; x36 -= l.y * x17; x36 -= l.z * x18; x36 -= l.w * x19; } { const v4f l = GDN_L4(36, 5); x36 -= l.x * x20; x36 -= l.y * x21; x36 -= l.z * x22; x36 -= l.w * x23; } { const v4f l = GDN_L4(36, 6); x36 -= l.x * x24; x36 -= l.y * x25; x36 -= l.z * x26; x36 -= l.w * x27; } { const v4f l = GDN_L4(36, 7); x36 -= l.x * x28; x36 -= l.y * x29; x36 -= l.z * x30; x36 -= l.w * x31; } { const v4f l = GDN_L4(36, 8); x36 -= l.x * x32; x36 -= l.y * x33; x36 -= l.z * x34; x36 -= l.w * x35; } __builtin_amdgcn_sched_barrier(0);
        float x37 = GDN_RHS(37); { const v4f l = GDN_L4(37, 0); x37 -= l.x * x0; x37 -= l.y * x1; x37 -= l.z * x2; x37 -= l.w * x3; } { const v4f l = GDN_L4(37, 1); x37 -= l.x * x4; x37 -= l.y * x5; x37 -= l.z * x6; x37 -= l.w * x7; } { const v4f l = GDN_L4(37, 2); x37 -= l.x * x8; x37 -= l.y * x9; x37 -= l.z * x10; x37 -= l.w * x11; } { const v4f l = GDN_L4(37, 3); x37 -= l.x * x12; x37 -= l.y * x13; x37 -= l.z * x14; x37 -= l.w * x15; } { const v4f l = GDN_L4(37, 4); x37 -= l.x * x16; x37 -= l.y * x17; x37 -= l.z * x18; x37 -= l.w * x19; } { const v4f l = GDN_L4(37, 5); x37 -= l.x * x20; x37 -= l.y * x21; x37 -= l.z * x22; x37 -= l.w * x23; } { const v4f l = GDN_L4(37, 6); x37 -= l.x * x24; x37 -= l.y * x25; x37 -= l.z * x26; x37 -= l.w * x27; } { const v4f l = GDN_L4(37, 7); x37 -= l.x * x28; x37 -= l.y * x29; x37 -= l.z * x30; x37 -= l.w * x31; } { const v4f l = GDN_L4(37, 8); x37 -= l.x * x32; x37 -= l.y * x33; x37 -= l.z * x34; x37 -= l.w * x35; } { const v4f l = GDN_L4(37, 9); x37 -= l.x * x36; } __builtin_amdgcn_sched_barrier(0);
        float x38 = GDN_RHS(38); { const v4f l = GDN_L4(38, 0); x38 -= l.x * x0; x38 -= l.y * x1; x38 -= l.z * x2; x38 -= l.w * x3; } { const v4f l = GDN_L4(38, 1); x38 -= l.x * x4; x38 -= l.y * x5; x38 -= l.z * x6; x38 -= l.w * x7; } { const v4f l = GDN_L4(38, 2); x38 -= l.x * x8; x38 -= l.y * x9; x38 -= l.z * x10; x38 -= l.w * x11; } { const v4f l = GDN_L4(38, 3); x38 -= l.x * x12; x38 -= l.y * x13; x38 -= l.z * x14; x38 -= l.w * x15; } { const v4f l = GDN_L4(38, 4); x38 -= l.x * x16; x38 -= l.y * x17; x38 -= l.z * x18; x38 -= l.w * x19; } { const v4f l = GDN_L4(38, 5); x38 -= l.x * x20; x38 -= l.y * x21; x38 -= l.z * x22; x38 -= l.w * x23; } { const v4f l = GDN_L4(38, 6); x38 -= l.x * x24; x38 -= l.y * x25; x38 -= l.z * x26; x38 -= l.w * x27; } { const v4f l = GDN_L4(38, 7); x38 -= l.x * x28; x38 -= l.y * x29; x38 -= l.z * x30; x38 -= l.w * x31; } { const v4f l = GDN_L4(38, 8); x38 -= l.x * x32; x38 -= l.y * x33; x38 -= l.z * x34; x38 -= l.w * x35; } { const v4f l = GDN_L4(38, 9); x38 -= l.x * x36; x38 -= l.y * x37; } __builtin_amdgcn_sched_barrier(0);
        float x39 = GDN_RHS(39); { const v4f l = GDN_L4(39, 0); x39 -= l.x * x0; x39 -= l.y * x1; x39 -= l.z * x2; x39 -= l.w * x3; } { const v4f l = GDN_L4(39, 1); x39 -= l.x * x4; x39 -= l.y * x5; x39 -= l.z * x6; x39 -= l.w * x7; } { const v4f l = GDN_L4(39, 2); x39 -= l.x * x8; x39 -= l.y * x9; x39 -= l.z * x10; x39 -= l.w * x11; } { const v4f l = GDN_L4(39, 3); x39 -= l.x * x12; x39 -= l.y * x13; x39 -= l.z * x14; x39 -= l.w * x15; } { const v4f l = GDN_L4(39, 4); x39 -= l.x * x16; x39 -= l.y * x17; x39 -= l.z * x18; x39 -= l.w * x19; } { const v4f l = GDN_L4(39, 5); x39 -= l.x * x20; x39 -= l.y * x21; x39 -= l.z * x22; x39 -= l.w * x23; } { const v4f l = GDN_L4(39, 6); x39 -= l.x * x24; x39 -= l.y * x25; x39 -= l.z * x26; x39 -= l.w * x27; } { const v4f l = GDN_L4(39, 7); x39 -= l.x * x28; x39 -= l.y * x29; x39 -= l.z * x30; x39 -= l.w * x31; } { const v4f l = GDN_L4(39, 8); x39 -= l.x * x32; x39 -= l.y * x33; x39 -= l.z * x34; x39 -= l.w * x35; } { const v4f l = GDN_L4(39, 9); x39 -= l.x * x36; x39 -= l.y * x37; x39 -= l.z * x38; } __builtin_amdgcn_sched_barrier(0);
        float x40 = GDN_RHS(40); { const v4f l = GDN_L4(40, 0); x40 -= l.x * x0; x40 -= l.y * x1; x40 -= l.z * x2; x40 -= l.w * x3; } { const v4f l = GDN_L4(40, 1); x40 -= l.x * x4; x40 -= l.y * x5; x40 -= l.z * x6; x40 -= l.w * x7; } { const v4f l = GDN_L4(40, 2); x40 -= l.x * x8; x40 -= l.y * x9; x40 -= l.z * x10; x40 -= l.w * x11; } { const v4f l = GDN_L4(40, 3); x40 -= l.x * x12; x40 -= l.y * x13; x40 -= l.z * x14; x40 -= l.w * x15; } { const v4f l = GDN_L4(40, 4); x40 -= l.x * x16; x40 -= l.y * x17; x40 -= l.z * x18; x40 -= l.w * x19; } { const v4f l = GDN_L4(40, 5); x40 -= l.x * x20; x40 -= l.y * x21; x40 -= l.z * x22; x40 -= l.w * x23; } { const v4f l = GDN_L4(40, 6); x40 -= l.x * x24; x40 -= l.y * x25; x40 -= l.z * x26; x40 -= l.w * x27; } { const v4f l = GDN_L4(40, 7); x40 -= l.x * x28; x40 -= l.y * x29; x40 -= l.z * x30; x40 -= l.w * x31; } { const v4f l = GDN_L4(40, 8); x40 -= l.x * x32; x40 -= l.y * x33; x40 -= l.z * x34; x40 -= l.w * x35; } { const v4f l = GDN_L4(40, 9); x40 -= l.x * x36; x40 -= l.y * x37; x40 -= l.z * x38; x40 -= l.w * x39; } __builtin_amdgcn_sched_barrier(0);
        float x41 = GDN_RHS(41); { const v4f l = GDN_L4(41, 0); x41 -= l.x * x0; x41 -= l.y * x1; x41 -= l.z * x2; x41 -= l.w * x3; } { const v4f l = GDN_L4(41, 1); x41 -= l.x * x4; x41 -= l.y * x5; x41 -= l.z * x6; x41 -= l.w * x7; } { const v4f l = GDN_L4(41, 2); x41 -= l.x * x8; x41 -= l.y * x9; x41 -= l.z * x10; x41 -= l.w * x11; } { const v4f l = GDN_L4(41, 3); x41 -= l.x * x12; x41 -= l.y * x13; x41 -= l.z * x14; x41 -= l.w * x15; } { const v4f l = GDN_L4(41, 4); x41 -= l.x * x16; x41 -= l.y * x17; x41 -= l.z * x18; x41 -= l.w * x19; } { const v4f l = GDN_L4(41, 5); x41 -= l.x * x20; x41 -= l.y * x21; x41 -= l.z * x22; x41 -= l.w * x23; } { const v4f l = GDN_L4(41, 6); x41 -= l.x * x24; x41 -= l.y * x25; x41 -= l.z * x26; x41 -= l.w * x27; } { const v4f l = GDN_L4(41, 7); x41 -= l.x * x28; x41 -= l.y * x29; x41 -= l.z * x30; x41 -= l.w * x31; } { const v4f l = GDN_L4(41, 8); x41 -= l.x * x32; x41 -= l.y * x33; x41 -= l.z * x34; x41 -= l.w * x35; } { const v4f l = GDN_L4(41, 9); x41 -= l.x * x36; x41 -= l.y * x37; x41 -= l.z * x38; x41 -= l.w * x39; } { const v4f l = GDN_L4(41, 10); x41 -= l.x * x40; } __builtin_amdgcn_sched_barrier(0);
        float x42 = GDN_RHS(42); { const v4f l = GDN_L4(42, 0); x42 -= l.x * x0; x42 -= l.y * x1; x42 -= l.z * x2; x42 -= l.w * x3; } { const v4f l = GDN_L4(42, 1); x42 -= l.x * x4; x42 -= l.y * x5; x42 -= l.z * x6; x42 -= l.w * x7; } { const v4f l = GDN_L4(42, 2); x42 -= l.x * x8; x42 -= l.y * x9; x42 -= l.z * x10; x42 -= l.w * x11; } { const v4f l = GDN_L4(42, 3); x42 -= l.x * x12; x42 -= l.y * x13; x42 -= l.z * x14; x42 -= l.w * x15; } { const v4f l = GDN_L4(42, 4); x42 -= l.x * x16; x42 -= l.y * x17; x42 -= l.z * x18; x42 -= l.w * x19; } { const v4f l = GDN_L4(42, 5); x42 -= l.x * x20; x42 -= l.y * x21; x42 -= l.z * x22; x42 -= l.w * x23; } { const v4f l = GDN_L4(42, 6); x42 -= l.x * x24; x42 -= l.y * x25; x42 -= l.z * x26; x42 -= l.w * x27; } { const v4f l = GDN_L4(42, 7); x42 -= l.x * x28; x42 -= l.y * x29; x42 -= l.z * x30; x42 -= l.w * x31; } { const v4f l = GDN_L4(42, 8); x42 -= l.x * x32; x42 -= l.y * x33; x42 -= l.z * x34; x42 -= l.w * x35; } { const v4f l = GDN_L4(42, 9); x42 -= l.x * x36; x42 -= l.y * x37; x42 -= l.z * x38; x42 -= l.w * x39; } { const v4f l = GDN_L4(42, 10); x42 -= l.x * x40; x42 -= l.y * x41; } __builtin_amdgcn_sched_barrier(0);
        float x43 = GDN_RHS(43); { const v4f l = GDN_L4(43, 0); x43 -= l.x * x0; x43 -= l.y * x1; x43 -= l.z * x2; x43 -= l.w * x3; } { const v4f l = GDN_L4(43, 1); x43 -= l.x * x4; x43 -= l.y * x5; x43 -= l.z * x6; x43 -= l.w * x7; } { const v4f l = GDN_L4(43, 2); x43 -= l.x * x8; x43 -= l.y * x9; x43 -= l.z * x10; x43 -= l.w * x11; } { const v4f l = GDN_L4(43, 3); x43 -= l.x * x12; x43 -= l.y * x13; x43 -= l.z * x14; x43 -= l.w * x15; } { const v4f l = GDN_L4(43, 4); x43 -= l.x * x16; x43 -= l.y * x17; x43 -= l.z * x18; x43 -= l.w * x19; } { const v4f l = GDN_L4(43, 5); x43 -= l.x * x20; x43 -= l.y * x21; x43 -= l.z * x22; x43 -= l.w * x23; } { const v4f l = GDN_L4(43, 6); x43 -= l.x * x24; x43 -= l.y * x25; x43 -= l.z * x26; x43 -= l.w * x27; } { const v4f l = GDN_L4(43, 7); x43 -= l.x * x28; x43 -= l.y * x29; x43 -= l.z * x30; x43 -= l.w * x31; } { const v4f l = GDN_L4(43, 8); x43 -= l.x * x32; x43 -= l.y * x33; x43 -= l.z * x34; x43 -= l.w * x35; } { const v4f l = GDN_L4(43, 9); x43 -= l.x * x36; x43 -= l.y * x37; x43 -= l.z * x38; x43 -= l.w * x39; } { const v4f l = GDN_L4(43, 10); x43 -= l.x * x40; x43 -= l.y * x41; x43 -= l.z * x42; } __builtin_amdgcn_sched_barrier(0);
        float x44 = GDN_RHS(44); { const v4f l = GDN_L4(44, 0); x44 -= l.x * x0; x44 -= l.y * x1; x44 -= l.z * x2; x44 -= l.w * x3; } { const v4f l = GDN_L4(44, 1); x44 -= l.x * x4; x44 -= l.y * x5; x44 -= l.z * x6; x44 -= l.w * x7; } { const v4f l = GDN_L4(44, 2); x44 -= l.x * x8; x44 -= l.y * x9; x44 -= l.z * x10; x44 -= l.w * x11; } { const v4f l = GDN_L4(44, 3); x44 -= l.x * x12; x44 -= l.y * x13; x44 -= l.z * x14; x44 -= l.w * x15; } { const v4f l = GDN_L4(44, 4); x44 -= l.x * x16; x44 -= l.y * x17; x44 -= l.z * x18; x44 -= l.w * x19; } { const v4f l = GDN_L4(44, 5); x44 -= l.x * x20; x44 -= l.y * x21; x44 -= l.z * x22; x44 -= l.w * x23; } { const v4f l = GDN_L4(44, 6); x44 -= l.x * x24; x44 -= l.y * x25; x44 -= l.z * x26; x44 -= l.w * x27; } { const v4f l = GDN_L4(44, 7); x44 -= l.x * x28; x44 -= l.y * x29; x44 -= l.z * x30; x44 -= l.w * x31; } { const v4f l = GDN_L4(44, 8); x44 -= l.x * x32; x44 -= l.y * x33; x44 -= l.z * x34; x44 -= l.w * x35; } { const v4f l = GDN_L4(44, 9); x44 -= l.x * x36; x44 -= l.y * x37; x44 -= l.z * x38; x44 -= l.w * x39; } { const v4f l = GDN_L4(44, 10); x44 -= l.x * x40; x44 -= l.y * x41; x44 -= l.z * x42; x44 -= l.w * x43; } __builtin_amdgcn_sched_barrier(0);
        float x45 = GDN_RHS(45); { const v4f l = GDN_L4(45, 0); x45 -= l.x * x0; x45 -= l.y * x1; x45 -= l.z * x2; x45 -= l.w * x3; } { const v4f l = GDN_L4(45, 1); x45 -= l.x * x4; x45 -= l.y * x5; x45 -= l.z * x6; x45 -= l.w * x7; } { const v4f l = GDN_L4(45, 2); x45 -= l.x * x8; x45 -= l.y * x9; x45 -= l.z * x10; x45 -= l.w * x11; } { const v4f l = GDN_L4(45, 3); x45 -= l.x * x12; x45 -= l.y * x13; x45 -= l.z * x14; x45 -= l.w * x15; } { const v4f l = GDN_L4(45, 4); x45 -= l.x * x16; x45 -= l.y * x17; x45 -= l.z * x18; x45 -= l.w * x19; } { const v4f l = GDN_L4(45, 5); x45 -= l.x * x20; x45 -= l.y * x21; x45 -= l.z * x22; x45 -= l.w * x23; } { const v4f l = GDN_L4(45, 6); x45 -= l.x * x24; x45 -= l.y * x25; x45 -= l.z * x26; x45 -= l.w * x27; } { const v4f l = GDN_L4(45, 7); x45 -= l.x * x28; x45 -= l.y * x29; x45 -= l.z * x30; x45 -= l.w * x31; } { const v4f l = GDN_L4(45, 8); x45 -= l.x * x32; x45 -= l.y * x33; x45 -= l.z * x34; x45 -= l.w * x35; } { const v4f l = GDN_L4(45, 9); x45 -= l.x * x36; x45 -= l.y * x37; x45 -= l.z * x38; x45 -= l.w * x39; } { const v4f l = GDN_L4(45, 10); x45 -= l.x * x40; x45 -= l.y * x41; x45 -= l.z * x42; x45 -= l.w * x43; } { const v4f l = GDN_L4(45, 11); x45 -= l.x * x44; } __builtin_amdgcn_sched_barrier(0);
        float x46 = GDN_RHS(46); { const v4f l = GDN_L4(46, 0); x46 -= l.x * x0; x46 -= l.y * x1; x46 -= l.z * x2; x46 -= l.w * x3; } { const v4f l = GDN_L4(46, 1); x46 -= l.x * x4; x46 -= l.y * x5; x46 -= l.z * x6; x46 -= l.w * x7; } { const v4f l = GDN_L4(46, 2); x46 -= l.x * x8; x46 -= l.y * x9; x46 -= l.z * x10; x46 -= l.w * x11; } { const v4f l = GDN_L4(46, 3); x46 -= l.x * x12; x46 -= l.y * x13; x46 -= l.z * x14; x46 -= l.w * x15; } { const v4f l = GDN_L4(46, 4); x46 -= l.x * x16; x46 -= l.y * x17; x46 -= l.z * x18; x46 -= l.w * x19; } { const v4f l = GDN_L4(46, 5); x46 -= l.x * x20; x46 -= l.y * x21; x46 -= l.z * x22; x46 -= l.w * x23; } { const v4f l = GDN_L4(46, 6); x46 -= l.x * x24; x46 -= l.y * x25; x46 -= l.z * x26; x46 -= l.w * x27; } { const v4f l = GDN_L4(46, 7); x46 -= l.x * x28; x46 -= l.y * x29; x46 -= l.z * x30; x46 -= l.w * x31; } { const v4f l = GDN_L4(46, 8); x46 -= l.x * x32; x46 -= l.y * x33; x46 -= l.z * x34; x46 -= l.w * x35; } { const v4f l = GDN_L4(46, 9); x46 -= l.x * x36; x46 -= l.y * x37; x46 -= l.z * x38; x46 -= l.w * x39; } { const v4f l = GDN_L4(46, 10); x46 -= l.x * x40; x46 -= l.y * x41; x46 -= l.z * x42; x46 -= l.w * x43; } { const v4f l = GDN_L4(46, 11); x46 -= l.x * x44; x46 -= l.y * x45; } __builtin_amdgcn_sched_barrier(0);
        float x47 = GDN_RHS(47); { const v4f l = GDN_L4(47, 0); x47 -= l.x * x0; x47 -= l.y * x1; x47 -= l.z * x2; x47 -= l.w * x3; } { const v4f l = GDN_L4(47, 1); x47 -= l.x * x4; x47 -= l.y * x5; x47 -= l.z * x6; x47 -= l.w * x7; } { const v4f l = GDN_L4(47, 2); x47 -= l.x * x8; x47 -= l.y * x9; x47 -= l.z * x10; x47 -= l.w * x11; } { const v4f l = GDN_L4(47, 3); x47 -= l.x * x12; x47 -= l.y * x13; x47 -= l.z * x14; x47 -= l.w * x15; } { const v4f l = GDN_L4(47, 4); x47 -= l.x * x16; x47 -= l.y * x17; x47 -= l.z * x18; x47 -= l.w * x19; } { const v4f l = GDN_L4(47, 5); x47 -= l.x * x20; x47 -= l.y * x21; x47 -= l.z * x22; x47 -= l.w * x23; } { const v4f l = GDN_L4(47, 6); x47 -= l.x * x24; x47 -= l.y * x25; x47 -= l.z * x26; x47 -= l.w * x27; } { const v4f l = GDN_L4(47, 7); x47 -= l.x * x28; x47 -= l.y * x29; x47 -= l.z * x30; x47 -= l.w * x31; } { const v4f l = GDN_L4(47, 8); x47 -= l.x * x32; x47 -= l.y * x33; x47 -= l.z * x34; x47 -= l.w * x35; } { const v4f l = GDN_L4(47, 9); x47 -= l.x * x36; x47 -= l.y * x37; x47 -= l.z * x38; x47 -= l.w * x39; } { const v4f l = GDN_L4(47, 10); x47 -= l.x * x40; x47 -= l.y * x41; x47 -= l.z * x42; x47 -= l.w * x43; } { const v4f l = GDN_L4(47, 11); x47 -= l.x * x44; x47 -= l.y * x45; x47 -= l.z * x46; } __builtin_amdgcn_sched_barrier(0);
        float x48 = GDN_RHS(48); { const v4f l = GDN_L4(48, 0); x48 -= l.x * x0; x48 -= l.y * x1; x48 -= l.z * x2; x48 -= l.w * x3; } { const v4f l = GDN_L4(48, 1); x48 -= l.x * x4; x48 -= l.y * x5; x48 -= l.z * x6; x48 -= l.w * x7; } { const v4f l = GDN_L4(48, 2); x48 -= l.x * x8; x48 -= l.y * x9; x48 -= l.z * x10; x48 -= l.w * x11; } { const v4f l = GDN_L4(48, 3); x48 -= l.x * x12; x48 -= l.y * x13; x48 -= l.z * x14; x48 -= l.w * x15; } { const v4f l = GDN_L4(48, 4); x48 -= l.x * x16; x48 -= l.y * x17; x48 -= l.z * x18; x48 -= l.w * x19; } { const v4f l = GDN_L4(48, 5); x48 -= l.x * x20; x48 -= l.y * x21; x48 -= l.z * x22; x48 -= l.w * x23; } { const v4f l = GDN_L4(48, 6); x48 -= l.x * x24; x48 -= l.y * x25; x48 -= l.z * x26; x48 -= l.w * x27; } { const v4f l = GDN_L4(48, 7); x48 -= l.x * x28; x48 -= l.y * x29; x48 -= l.z * x30; x48 -= l.w * x31; } { const v4f l = GDN_L4(48, 8); x48 -= l.x * x32; x48 -= l.y * x33; x48 -= l.z * x34; x48 -= l.w * x35; } { const v4f l = GDN_L4(48, 9); x48 -= l.x * x36; x48 -= l.y * x37; x48 -= l.z * x38; x48 -= l.w * x39; } { const v4f l = GDN_L4(48, 10); x48 -= l.x * x40; x48 -= l.y * x41; x48 -= l.z * x42; x48 -= l.w * x43; } { const v4f l = GDN_L4(48, 11); x48 -= l.x * x44; x48 -= l.y * x45; x48 -= l.z * x46; x48 -= l.w * x47; } __builtin_amdgcn_sched_barrier(0);
        float x49 = GDN_RHS(49); { const v4f l = GDN_L4(49, 0); x49 -= l.x * x0; x49 -= l.y * x1; x49 -= l.z * x2; x49 -= l.w * x3; } { const v4f l = GDN_L4(49, 1); x49 -= l.x * x4; x49 -= l.y * x5; x49 -= l.z * x6; x49 -= l.w * x7; } { const v4f l = GDN_L4(49, 2); x49 -= l.x * x8; x49 -= l.y * x9; x49 -= l.z * x10; x49 -= l.w * x11; } { const v4f l = GDN_L4(49, 3); x49 -= l.x * x12; x49 -= l.y * x13; x49 -= l.z * x14; x49 -= l.w * x15; } { const v4f l = GDN_L4(49, 4); x49 -= l.x * x16; x49 -= l.y * x17; x49 -= l.z * x18; x49 -= l.w * x19; } { const v4f l = GDN_L4(49, 5); x49 -= l.x * x20; x49 -= l.y * x21; x49 -= l.z * x22; x49 -= l.w * x23; } { const v4f l = GDN_L4(49, 6); x49 -= l.x * x24; x49 -= l.y * x25; x49 -= l.z * x26; x49 -= l.w * x27; } { const v4f l = GDN_L4(49, 7); x49 -= l.x * x28; x49 -= l.y * x29; x49 -= l.z * x30; x49 -= l.w * x31; } { const v4f l = GDN_L4(49, 8); x49 -= l.x * x32; x49 -= l.y * x33; x49 -= l.z * x34; x49 -= l.w * x35; } { const v4f l = GDN_L4(49, 9); x49 -= l.x * x36; x49 -= l.y * x37; x49 -= l.z * x38; x49 -= l.w * x39; } { const v4f l = GDN_L4(49, 10); x49 -= l.x * x40; x49 -= l.y * x41; x49 -= l.z * x42; x49 -= l.w * x43; } { const v4f l = GDN_L4(49, 11); x49 -= l.x * x44; x49 -= l.y * x45; x49 -= l.z * x46; x49 -= l.w * x47; } { const v4f l = GDN_L4(49, 12); x49 -= l.x * x48; } __builtin_amdgcn_sched_barrier(0);
        float x50 = GDN_RHS(50); { const v4f l = GDN_L4(50, 0); x50 -= l.x * x0; x50 -= l.y * x1; x50 -= l.z * x2; x50 -= l.w * x3; } { const v4f l = GDN_L4(50, 1); x50 -= l.x * x4; x50 -= l.y * x5; x50 -= l.z * x6; x50 -= l.w * x7; } { const v4f l = GDN_L4(50, 2); x50 -= l.x * x8; x50 -= l.y * x9; x50 -= l.z * x10; x50 -= l.w * x11; } { const v4f l = GDN_L4(50, 3); x50 -= l.x * x12; x50 -= l.y * x13; x50 -= l.z * x14; x50 -= l.w * x15; } { const v4f l = GDN_L4(50, 4); x50 -= l.x * x16; x50 -= l.y * x17; x50 -= l.z * x18; x50 -= l.w * x19; } { const v4f l = GDN_L4(50, 5); x50 -= l.x * x20; x50 -= l.y * x21; x50 -= l.z * x22; x50 -= l.w * x23; } { const v4f l = GDN_L4(50, 6); x50 -= l.x * x24; x50 -= l.y * x25; x50 -= l.z * x26; x50 -= l.w * x27; } { const v4f l = GDN_L4(50, 7); x50 -= l.x * x28; x50 -= l.y * x29; x50 -= l.z * x30; x50 -= l.w * x31; } { const v4f l = GDN_L4(50, 8); x50 -= l.x * x32; x50 -= l.y * x33; x50 -= l.z * x34; x50 -= l.w * x35; } { const v4f l = GDN_L4(50, 9); x50 -= l.x * x36; x50 -= l.y * x37; x50 -= l.z * x38; x50 -= l.w * x39; } { const v4f l = GDN_L4(50, 10); x50 -= l.x * x40; x50 -= l.y * x41; x50 -= l.z * x42; x50 -= l.w * x43; } { const v4f l = GDN_L4(50, 11); x50 -= l.x * x44; x50 -= l.y * x45; x50 -= l.z * x46; x50 -= l.w * x47; } { const v4f l = GDN_L4(50, 12); x50 -= l.x * x48; x50 -= l.y * x49; } __builtin_amdgcn_sched_barrier(0);
        float x51 = GDN_RHS(51); { const v4f l = GDN_L4(51, 0); x51 -= l.x * x0; x51 -= l.y * x1; x51 -= l.z * x2; x51 -= l.w * x3; } { const v4f l = GDN_L4(51, 1); x51 -= l.x * x4; x51 -= l.y * x5; x51 -= l.z * x6; x51 -= l.w * x7; } { const v4f l = GDN_L4(51, 2); x51 -= l.x * x8; x51 -= l.y * x9; x51 -= l.z * x10; x51 -= l.w * x11; } { const v4f l = GDN_L4(51, 3); x51 -= l.x * x12; x51 -= l.y * x13; x51 -= l.z * x14; x51 -= l.w * x15; } { const v4f l = GDN_L4(51, 4); x51 -= l.x * x16; x51 -= l.y * x17; x51 -= l.z * x18; x51 -= l.w * x19; } { const v4f l = GDN_L4(51, 5); x51 -= l.x * x20; x51 -= l.y * x21; x51 -= l.z * x22; x51 -= l.w * x23; } { const v4f l = GDN_L4(51, 6); x51 -= l.x * x24; x51 -= l.y * x25; x51 -= l.z * x26; x51 -= l.w * x27; } { const v4f l = GDN_L4(51, 7); x51 -= l.x * x28; x51 -= l.y * x29; x51 -= l.z * x30; x51 -= l.w * x31; } { const v4f l = GDN_L4(51, 8); x51 -= l.x * x32; x51 -= l.y * x33; x51 -= l.z * x34; x51 -= l.w * x35; } { const v4f l = GDN_L4(51, 9); x51 -= l.x * x36; x51 -= l.y * x37; x51 -= l.z * x38; x51 -= l.w * x39; } { const v4f l = GDN_L4(51, 10); x51 -= l.x * x40; x51 -= l.y * x41; x51 -= l.z * x42; x51 -= l.w * x43; } { const v4f l = GDN_L4(51, 11); x51 -= l.x * x44; x51 -= l.y * x45; x51 -= l.z * x46; x51 -= l.w * x47; } { const v4f l = GDN_L4(51, 12); x51 -= l.x * x48; x51 -= l.y * x49; x51 -= l.z * x50; } __builtin_amdgcn_sched_barrier(0);
        float x52 = GDN_RHS(52); { const v4f l = GDN_L4(52, 0); x52 -= l.x * x0; x52 -= l.y * x1; x52 -= l.z * x2; x52 -= l.w * x3; } { const v4f l = GDN_L4(52, 1); x52 -= l.x * x4; x52 -= l.y * x5; x52 -= l.z * x6; x52 -= l.w * x7; } { const v4f l = GDN_L4(52, 2); x52 -= l.x * x8; x52 -= l.y * x9; x52 -= l.z * x10; x52 -= l.w * x11; } { const v4f l = GDN_L4(52, 3); x52 -= l.x * x12; x52 -= l.y * x13; x52 -= l.z * x14; x52 -= l.w * x15; } { const v4f l = GDN_L4(52, 4); x52 -= l.x * x16; x52 -= l.y * x17; x52 -= l.z * x18; x52 -= l.w * x19; } { const v4f l = GDN_L4(52, 5); x52 -= l.x * x20; x52 -= l.y * x21; x52 -= l.z * x22; x52 -= l.w * x23; } { const v4f l = GDN_L4(52, 6); x52 -= l.x * x24; x52 -= l.y * x25; x52 -= l.z * x26; x52 -= l.w * x27; } { const v4f l = GDN_L4(52, 7); x52 -= l.x * x28; x52 -= l.y * x29; x52 -= l.z * x30; x52 -= l.w * x31; } { const v4f l = GDN_L4(52, 8); x52 -= l.x * x32; x52 -= l.y * x33; x52 -= l.z * x34; x52 -= l.w * x35; } { const v4f l = GDN_L4(52, 9); x52 -= l.x * x36; x52 -= l.y * x37; x52 -= l.z * x38; x52 -= l.w * x39; } { const v4f l = GDN_L4(52, 10); x52 -= l.x * x40; x52 -= l.y * x41; x52 -= l.z * x42; x52 -= l.w * x43; } { const v4f l = GDN_L4(52, 11); x52 -= l.x * x44; x52 -= l.y * x45; x52 -= l.z * x46; x52 -= l.w * x47; } { const v4f l = GDN_L4(52, 12); x52 -= l.x * x48; x52 -= l.y * x49; x52 -= l.z * x50; x52 -= l.w * x51; } __builtin_amdgcn_sched_barrier(0);
        float x53 = GDN_RHS(53); { const v4f l = GDN_L4(53, 0); x53 -= l.x * x0; x53 -= l.y * x1; x53 -= l.z * x2; x53 -= l.w * x3; } { const v4f l = GDN_L4(53, 1); x53 -= l.x * x4; x53 -= l.y * x5; x53 -= l.z * x6; x53 -= l.w * x7; } { const v4f l = GDN_L4(53, 2); x53 -= l.x * x8; x53 -= l.y * x9; x53 -= l.z * x10; x53 -= l.w * x11; } { const v4f l = GDN_L4(53, 3); x53 -= l.x * x12; x53 -= l.y * x13; x53 -= l.z * x14; x53 -= l.w * x15; } { const v4f l = GDN_L4(53, 4); x53 -= l.x * x16; x53 -= l.y * x17; x53 -= l.z * x18; x53 -= l.w * x19; } { const v4f l = GDN_L4(53, 5); x53 -= l.x * x20; x53 -= l.y * x21; x53 -= l.z * x22; x53 -= l.w * x23; } { const v4f l = GDN_L4(53, 6); x53 -= l.x * x24; x53 -= l.y * x25; x53 -= l.z * x26; x53 -= l.w * x27; } { const v4f l = GDN_L4(53, 7); x53 -= l.x * x28; x53 -= l.y * x29; x53 -= l.z * x30; x53 -= l.w * x31; } { const v4f l = GDN_L4(53, 8); x53 -= l.x * x32; x53 -= l.y * x33; x53 -= l.z * x34; x53 -= l.w * x35; } { const v4f l = GDN_L4(53, 9); x53 -= l.x * x36; x53 -= l.y * x37; x53 -= l.z * x38; x53 -= l.w * x39; } { const v4f l = GDN_L4(53, 10); x53 -= l.x * x40; x53 -= l.y * x41; x53 -= l.z * x42; x53 -= l.w * x43; } { const v4f l = GDN_L4(53, 11); x53 -= l.x * x44; x53 -= l.y * x45; x53 -= l.z * x46; x53 -= l.w * x47; } { const v4f l = GDN_L4(53, 12); x53 -= l.x * x48; x53 -= l.y * x49; x53 -= l.z * x50; x53 -= l.w * x51; } { const v4f l = GDN_L4(53, 13); x53 -= l.x * x52; } __builtin_amdgcn_sched_barrier(0);
        float x54 = GDN_RHS(54); { const v4f l = GDN_L4(54, 0); x54 -= l.x * x0; x54 -= l.y * x1; x54 -= l.z * x2; x54 -= l.w * x3; } { const v4f l = GDN_L4(54, 1); x54 -= l.x * x4; x54 -= l.y * x5; x54 -= l.z * x6; x54 -= l.w * x7; } { const v4f l = GDN_L4(54, 2); x54 -= l.x * x8; x54 -= l.y * x9; x54 -= l.z * x10; x54 -= l.w * x11; } { const v4f l = GDN_L4(54, 3); x54 -= l.x * x12; x54 -= l.y * x13; x54 -= l.z * x14; x54 -= l.w * x15; } { const v4f l = GDN_L4(54, 4); x54 -= l.x * x16; x54 -= l.y * x17; x54 -= l.z * x18; x54 -= l.w * x19; } { const v4f l = GDN_L4(54, 5); x54 -= l.x * x20; x54 -= l.y * x21; x54 -= l.z * x22; x54 -= l.w * x23; } { const v4f l = GDN_L4(54, 6); x54 -= l.x * x24; x54 -= l.y * x25; x54 -= l.z * x26; x54 -= l.w * x27; } { const v4f l = GDN_L4(54, 7); x54 -= l.x * x28; x54 -= l.y * x29; x54 -= l.z * x30; x54 -= l.w * x31; } { const v4f l = GDN_L4(54, 8); x54 -= l.x * x32; x54 -= l.y * x33; x54 -= l.z * x34; x54 -= l.w * x35; } { const v4f l = GDN_L4(54, 9); x54 -= l.x * x36; x54 -= l.y * x37; x54 -= l.z * x38; x54 -= l.w * x39; } { const v4f l = GDN_L4(54, 10); x54 -= l.x * x40; x54 -= l.y * x41; x54 -= l.z * x42; x54 -= l.w * x43; } { const v4f l = GDN_L4(54, 11); x54 -= l.x * x44; x54 -= l.y * x45; x54 -= l.z * x46; x54 -= l.w * x47; } { const v4f l = GDN_L4(54, 12); x54 -= l.x * x48; x54 -= l.y * x49; x54 -= l.z * x50; x54 -= l.w * x51; } { const v4f l = GDN_L4(54, 13); x54 -= l.x * x52; x54 -= l.y * x53; } __builtin_amdgcn_sched_barrier(0);
        float x55 = GDN_RHS(55); { const v4f l = GDN_L4(55, 0); x55 -= l.x * x0; x55 -= l.y * x1; x55 -= l.z * x2; x55 -= l.w * x3; } { const v4f l = GDN_L4(55, 1); x55 -= l.x * x4; x55 -= l.y * x5; x55 -= l.z * x6; x55 -= l.w * x7; } { const v4f l = GDN_L4(55, 2); x55 -= l.x * x8; x55 -= l.y * x9; x55 -= l.z * x10; x55 -= l.w * x11; } { const v4f l = GDN_L4(55, 3); x55 -= l.x * x12; x55 -= l.y * x13; x55 -= l.z * x14; x55 -= l.w * x15; } { const v4f l = GDN_L4(55, 4); x55 -= l.x * x16; x55 -= l.y * x17; x55 -= l.z * x18; x55 -= l.w * x19; } { const v4f l = GDN_L4(55, 5); x55 -= l.x * x20; x55 -= l.y * x21; x55 -= l.z * x22; x55 -= l.w * x23; } { const v4f l = GDN_L4(55, 6); x55 -= l.x * x24; x55 -= l.y * x25; x55 -= l.z * x26; x55 -= l.w * x27; } { const v4f l = GDN_L4(55, 7); x55 -= l.x * x28; x55 -= l.y * x29; x55 -= l.z * x30; x55 -= l.w * x31; } { const v4f l = GDN_L4(55, 8); x55 -= l.x * x32; x55 -= l.y * x33; x55 -= l.z * x34; x55 -= l.w * x35; } { const v4f l = GDN_L4(55, 9); x55 -= l.x * x36; x55 -= l.y * x37; x55 -= l.z * x38; x55 -= l.w * x39; } { const v4f l = GDN_L4(55, 10); x55 -= l.x * x40; x55 -= l.y * x41; x55 -= l.z * x42; x55 -= l.w * x43; } { const v4f l = GDN_L4(55, 11); x55 -= l.x * x44; x55 -= l.y * x45; x55 -= l.z * x46; x55 -= l.w * x47; } { const v4f l = GDN_L4(55, 12); x55 -= l.x * x48; x55 -= l.y * x49; x55 -= l.z * x50; x55 -= l.w * x51; } { const v4f l = GDN_L4(55, 13); x55 -= l.x * x52; x55 -= l.y * x53; x55 -= l.z * x54; } __builtin_amdgcn_sched_barrier(0);
        float x56 = GDN_RHS(56); { const v4f l = GDN_L4(56, 0); x56 -= l.x * x0; x56 -= l.y * x1; x56 -= l.z * x2; x56 -= l.w * x3; } { const v4f l = GDN_L4(56, 1); x56 -= l.x * x4; x56 -= l.y * x5; x56 -= l.z * x6; x56 -= l.w * x7; } { const v4f l = GDN_L4(56, 2); x56 -= l.x * x8; x56 -= l.y * x9; x56 -= l.z * x10; x56 -= l.w * x11; } { const v4f l = GDN_L4(56, 3); x56 -= l.x * x12; x56 -= l.y * x13; x56 -= l.z * x14; x56 -= l.w * x15; } { const v4f l = GDN_L4(56, 4); x56 -= l.x * x16; x56 -= l.y * x17; x56 -= l.z * x18; x56 -= l.w * x19; } { const v4f l = GDN_L4(56, 5); x56 -= l.x * x20; x56 -= l.y * x21; x56 -= l.z * x22; x56 -= l.w * x23; } { const v4f l = GDN_L4(56, 6); x56 -= l.x * x24; x56 -= l.y * x25; x56 -= l.z * x26; x56 -= l.w * x27; } { const v4f l = GDN_L4(56, 7); x56 -= l.x * x28; x56 -= l.y * x29; x56 -= l.z * x30; x56 -= l.w * x31; } { const v4f l = GDN_L4(56, 8); x56 -= l.x * x32; x56 -= l.y * x33; x56 -= l.z * x34; x56 -= l.w * x35; } { const v4f l = GDN_L4(56, 9); x56 -= l.x * x36; x56 -= l.y * x37; x56 -= l.z * x38; x56 -= l.w * x39; } { const v4f l = GDN_L4(56, 10); x56 -= l.x * x40; x56 -= l.y * x41; x56 -= l.z * x42; x56 -= l.w * x43; } { const v4f l = GDN_L4(56, 11); x56 -= l.x * x44; x56 -= l.y * x45; x56 -= l.z * x46; x56 -= l.w * x47; } { const v4f l = GDN_L4(56, 12); x56 -= l.x * x48; x56 -= l.y * x49; x56 -= l.z * x50; x56 -= l.w * x51; } { const v4f l = GDN_L4(56, 13); x56 -= l.x * x52; x56 -= l.y * x53; x56 -= l.z * x54; x56 -= l.w * x55; } __builtin_amdgcn_sched_barrier(0);
        float x57 = GDN_RHS(57); { const v4f l = GDN_L4(57, 0); x57 -= l.x * x0; x57 -= l.y * x1; x57 -= l.z * x2; x57 -= l.w * x3; } { const v4f l = GDN_L4(57, 1); x57 -= l.x * x4; x57 -= l.y * x5; x57 -= l.z * x6; x57 -= l.w * x7; } { const v4f l = GDN_L4(57, 2); x57 -= l.x * x8; x57 -= l.y * x9; x57 -= l.z * x10; x57 -= l.w * x11; } { const v4f l = GDN_L4(57, 3); x57 -= l.x * x12; x57 -= l.y * x13; x57 -= l.z * x14; x57 -= l.w * x15; } { const v4f l = GDN_L4(57, 4); x57 -= l.x * x16; x57 -= l.y * x17; x57 -= l.z * x18; x57 -= l.w * x19; } { const v4f l = GDN_L4(57, 5); x57 -= l.x * x20; x57 -= l.y * x21; x57 -= l.z * x22; x57 -= l.w * x23; } { const v4f l = GDN_L4(57, 6); x57 -= l.x * x24; x57 -= l.y * x25; x57 -= l.z * x26; x57 -= l.w * x27; } { const v4f l = GDN_L4(57, 7); x57 -= l.x * x28; x57 -= l.y * x29; x57 -= l.z * x30; x57 -= l.w * x31; } { const v4f l = GDN_L4(57, 8); x57 -= l.x * x32; x57 -= l.y * x33; x57 -= l.z * x34; x57 -= l.w * x35; } { const v4f l = GDN_L4(57, 9); x57 -= l.x * x36; x57 -= l.y * x37; x57 -= l.z * x38; x57 -= l.w * x39; } { const v4f l = GDN_L4(57, 10); x57 -= l.x * x40; x57 -= l.y * x41; x57 -= l.z * x42; x57 -= l.w * x43; } { const v4f l = GDN_L4(57, 11); x57 -= l.x * x44; x57 -= l.y * x45; x57 -= l.z * x46; x57 -= l.w * x47; } { const v4f l = GDN_L4(57, 12); x57 -= l.x * x48; x57 -= l.y * x49; x57 -= l.z * x50; x57 -= l.w * x51; } { const v4f l = GDN_L4(57, 13); x57 -= l.x * x52; x57 -= l.y * x53; x57 -= l.z * x54; x57 -= l.w * x55; } { const v4f l = GDN_L4(57, 14); x57 -= l.x * x56; } __builtin_amdgcn_sched_barrier(0);
        float x58 = GDN_RHS(58); { const v4f l = GDN_L4(58, 0); x58 -= l.x * x0; x58 -= l.y * x1; x58 -= l.z * x2; x58 -= l.w * x3; } { const v4f l = GDN_L4(58, 1); x58 -= l.x * x4; x58 -= l.y * x5; x58 -= l.z * x6; x58 -= l.w * x7; } { const v4f l = GDN_L4(58, 2); x58 -= l.x * x8; x58 -= l.y * x9; x58 -= l.z * x10; x58 -= l.w * x11; } { const v4f l = GDN_L4(58, 3); x58 -= l.x * x12; x58 -= l.y * x13; x58 -= l.z * x14; x58 -= l.w * x15; } { const v4f l = GDN_L4(58, 4); x58 -= l.x * x16; x58 -= l.y * x17; x58 -= l.z * x18; x58 -= l.w * x19; } { const v4f l = GDN_L4(58, 5); x58 -= l.x * x20; x58 -= l.y * x21; x58 -= l.z * x22; x58 -= l.w * x23; } { const v4f l = GDN_L4(58, 6); x58 -= l.x * x24; x58 -= l.y * x25; x58 -= l.z * x26; x58 -= l.w * x27; } { const v4f l = GDN_L4(58, 7); x58 -= l.x * x28; x58 -= l.y * x29; x58 -= l.z * x30; x58 -= l.w * x31; } { const v4f l = GDN_L4(58, 8); x58 -= l.x * x32; x58 -= l.y * x33; x58 -= l.z * x34; x58 -= l.w * x35; } { const v4f l = GDN_L4(58, 9); x58 -= l.x * x36; x58 -= l.y * x37; x58 -= l.z * x38; x58 -= l.w * x39; } { const v4f l = GDN_L4(58, 10); x58 -= l.x * x40; x58 -= l.y * x41; x58 -= l.z * x42; x58 -= l.w * x43; } { const v4f l = GDN_L4(58, 11); x58 -= l.x * x44; x58 -= l.y * x45; x58 -= l.z * x46; x58 -= l.w * x47; } { const v4f l = GDN_L4(58, 12); x58 -= l.x * x48; x58 -= l.y * x49; x58 -= l.z * x50; x58 -= l.w * x51; } { const v4f l = GDN_L4(58, 13); x58 -= l.x * x52; x58 -= l.y * x53; x58 -= l.z * x54; x58 -= l.w * x55; } { const v4f l = GDN_L4(58, 14); x58 -= l.x * x56; x58 -= l.y * x57; } __builtin_amdgcn_sched_barrier(0);
        float x59 = GDN_RHS(59); { const v4f l = GDN_L4(59, 0); x59 -= l.x * x0; x59 -= l.y * x1; x59 -= l.z * x2; x59 -= l.w * x3; } { const v4f l = GDN_L4(59, 1); x59 -= l.x * x4; x59 -= l.y * x5; x59 -= l.z * x6; x59 -= l.w * x7; } { const v4f l = GDN_L4(59, 2); x59 -= l.x * x8; x59 -= l.y * x9; x59 -= l.z * x10; x59 -= l.w * x11; } { const v4f l = GDN_L4(59, 3); x59 -= l.x * x12; x59 -= l.y * x13; x59 -= l.z * x14; x59 -= l.w * x15; } { const v4f l = GDN_L4(59, 4); x59 -= l.x * x16; x59 -= l.y * x17; x59 -= l.z * x18; x59 -= l.w * x19; } { const v4f l = GDN_L4(59, 5); x59 -= l.x * x20; x59 -= l.y * x21; x59 -= l.z * x22; x59 -= l.w * x23; } { const v4f l = GDN_L4(59, 6); x59 -= l.x * x24; x59 -= l.y * x25; x59 -= l.z * x26; x59 -= l.w * x27; } { const v4f l = GDN_L4(59, 7); x59 -= l.x * x28; x59 -= l.y * x29; x59 -= l.z * x30; x59 -= l.w * x31; } { const v4f l = GDN_L4(59, 8); x59 -= l.x * x32; x59 -= l.y * x33; x59 -= l.z * x34; x59 -= l.w * x35; } { const v4f l = GDN_L4(59, 9); x59 -= l.x * x36; x59 -= l.y * x37; x59 -= l.z * x38; x59 -= l.w * x39; } { const v4f l = GDN_L4(59, 10); x59 -= l.x * x40; x59 -= l.y * x41; x59 -= l.z * x42; x59 -= l.w * x43; } { const v4f l = GDN_L4(59, 11); x59 -= l.x * x44; x59 -= l.y * x45; x59 -= l.z * x46; x59 -= l.w * x47; } { const v4f l = GDN_L4(59, 12); x59 -= l.x * x48; x59 -= l.y * x49; x59 -= l.z * x50; x59 -= l.w * x51; } { const v4f l = GDN_L4(59, 13); x59 -= l.x * x52; x59 -= l.y * x53; x59 -= l.z * x54; x59 -= l.w * x55; } { const v4f l = GDN_L4(59, 14); x59 -= l.x * x56; x59 -= l.y * x57; x59 -= l.z * x58; } __builtin_amdgcn_sched_barrier(0);
        float x60 = GDN_RHS(60); { const v4f l = GDN_L4(60, 0); x60 -= l.x * x0; x60 -= l.y * x1; x60 -= l.z * x2; x60 -= l.w * x3; } { const v4f l = GDN_L4(60, 1); x60 -= l.x * x4; x60 -= l.y * x5; x60 -= l.z * x6; x60 -= l.w * x7; } { const v4f l = GDN_L4(60, 2); x60 -= l.x * x8; x60 -= l.y * x9; x60 -= l.z * x10; x60 -= l.w * x11; } { const v4f l = GDN_L4(60, 3); x60 -= l.x * x12; x60 -= l.y * x13; x60 -= l.z * x14; x60 -= l.w * x15; } { const v4f l = GDN_L4(60, 4); x60 -= l.x * x16; x60 -= l.y * x17; x60 -= l.z * x18; x60 -= l.w * x19; } { const v4f l = GDN_L4(60, 5); x60 -= l.x * x20; x60 -= l.y * x21; x60 -= l.z * x22; x60 -= l.w * x23; } { const v4f l = GDN_L4(60, 6); x60 -= l.x * x24; x60 -= l.y * x25; x60 -= l.z * x26; x60 -= l.w * x27; } { const v4f l = GDN_L4(60, 7); x60 -= l.x * x28; x60 -= l.y * x29; x60 -= l.z * x30; x60 -= l.w * x31; } { const v4f l = GDN_L4(60, 8); x60 -= l.x * x32; x60 -= l.y * x33; x60 -= l.z * x34; x60 -= l.w * x35; } { const v4f l = GDN_L4(60, 9); x60 -= l.x * x36; x60 -= l.y * x37; x60 -= l.z * x38; x60 -= l.w * x39; } { const v4f l = GDN_L4(60, 10); x60 -= l.x * x40; x60 -= l.y * x41; x60 -= l.z * x42; x60 -= l.w * x43; } { const v4f l = GDN_L4(60, 11); x60 -= l.x * x44; x60 -= l.y * x45; x60 -= l.z * x46; x60 -= l.w * x47; } { const v4f l = GDN_L4(60, 12); x60 -= l.x * x48; x60 -= l.y * x49; x60 -= l.z * x50; x60 -= l.w * x51; } { const v4f l = GDN_L4(60, 13); x60 -= l.x * x52; x60 -= l.y * x53; x60 -= l.z * x54; x60 -= l.w * x55; } { const v4f l = GDN_L4(60, 14); x60 -= l.x * x56; x60 -= l.y * x57; x60 -= l.z * x58; x60 -= l.w * x59; } __builtin_amdgcn_sched_barrier(0);
        float x61 = GDN_RHS(61); { const v4f l = GDN_L4(61, 0); x61 -= l.x * x0; x61 -= l.y * x1; x61 -= l.z * x2; x61 -= l.w * x3; } { const v4f l = GDN_L4(61, 1); x61 -= l.x * x4; x61 -= l.y * x5; x61 -= l.z * x6; x61 -= l.w * x7; } { const v4f l = GDN_L4(61, 2); x61 -= l.x * x8; x61 -= l.y * x9; x61 -= l.z * x10; x61 -= l.w * x11; } { const v4f l = GDN_L4(61, 3); x61 -= l.x * x12; x61 -= l.y * x13; x61 -= l.z * x14; x61 -= l.w * x15; } { const v4f l = GDN_L4(61, 4); x61 -= l.x * x16; x61 -= l.y * x17; x61 -= l.z * x18; x61 -= l.w * x19; } { const v4f l = GDN_L4(61, 5); x61 -= l.x * x20; x61 -= l.y * x21; x61 -= l.z * x22; x61 -= l.w * x23; } { const v4f l = GDN_L4(61, 6); x61 -= l.x * x24; x61 -= l.y * x25; x61 -= l.z * x26; x61 -= l.w * x27; } { const v4f l = GDN_L4(61, 7); x61 -= l.x * x28; x61 -= l.y * x29; x61 -= l.z * x30; x61 -= l.w * x31; } { const v4f l = GDN_L4(61, 8); x61 -= l.x * x32; x61 -= l.y * x33; x61 -= l.z * x34; x61 -= l.w * x35; } { const v4f l = GDN_L4(61, 9); x61 -= l.x * x36; x61 -= l.y * x37; x61 -= l.z * x38; x61 -= l.w * x39; } { const v4f l = GDN_L4(61, 10); x61 -= l.x * x40; x61 -= l.y * x41; x61 -= l.z * x42; x61 -= l.w * x43; } { const v4f l = GDN_L4(61, 11); x61 -= l.x * x44; x61 -= l.y * x45; x61 -= l.z * x46; x61 -= l.w * x47; } { const v4f l = GDN_L4(61, 12); x61 -= l.x * x48; x61 -= l.y * x49; x61 -= l.z * x50; x61 -= l.w * x51; } { const v4f l = GDN_L4(61, 13); x61 -= l.x * x52; x61 -= l.y * x53; x61 -= l.z * x54; x61 -= l.w * x55; } { const v4f l = GDN_L4(61, 14); x61 -= l.x * x56; x61 -= l.y * x57; x61 -= l.z * x58; x61 -= l.w * x59; } { const v4f l = GDN_L4(61, 15); x61 -= l.x * x60; } __builtin_amdgcn_sched_barrier(0);
        float x62 = GDN_RHS(62); { const v4f l = GDN_L4(62, 0); x62 -= l.x * x0; x62 -= l.y * x1; x62 -= l.z * x2; x62 -= l.w * x3; } { const v4f l = GDN_L4(62, 1); x62 -= l.x * x4; x62 -= l.y * x5; x62 -= l.z * x6; x62 -= l.w * x7; } { const v4f l = GDN_L4(62, 2); x62 -= l.x * x8; x62 -= l.y * x9; x62 -= l.z * x10; x62 -= l.w * x11; } { const v4f l = GDN_L4(62, 3); x62 -= l.x * x12; x62 -= l.y * x13; x62 -= l.z * x14; x62 -= l.w * x15; } { const v4f l = GDN_L4(62, 4); x62 -= l.x * x16; x62 -= l.y * x17; x62 -= l.z * x18; x62 -= l.w * x19; } { const v4f l = GDN_L4(62, 5); x62 -= l.x * x20; x62 -= l.y * x21; x62 -= l.z * x22; x62 -= l.w * x23; } { const v4f l = GDN_L4(62, 6); x62 -= l.x * x24; x62 -= l.y * x25; x62 -= l.z * x26; x62 -= l.w * x27; } { const v4f l = GDN_L4(62, 7); x62 -= l.x * x28; x62 -= l.y * x29; x62 -= l.z * x30; x62 -= l.w * x31; } { const v4f l = GDN_L4(62, 8); x62 -= l.x * x32; x62 -= l.y * x33; x62 -= l.z * x34; x62 -= l.w * x35; } { const v4f l = GDN_L4(62, 9); x62 -= l.x * x36; x62 -= l.y * x37; x62 -= l.z * x38; x62 -= l.w * x39; } { const v4f l = GDN_L4(62, 10); x62 -= l.x * x40; x62 -= l.y * x41; x62 -= l.z * x42; x62 -= l.w * x43; } { const v4f l = GDN_L4(62, 11); x62 -= l.x * x44; x62 -= l.y * x45; x62 -= l.z * x46; x62 -= l.w * x47; } { const v4f l = GDN_L4(62, 12); x62 -= l.x * x48; x62 -= l.y * x49; x62 -= l.z * x50; x62 -= l.w * x51; } { const v4f l = GDN_L4(62, 13); x62 -= l.x * x52; x62 -= l.y * x53; x62 -= l.z * x54; x62 -= l.w * x55; } { const v4f l = GDN_L4(62, 14); x62 -= l.x * x56; x62 -= l.y * x57; x62 -= l.z * x58; x62 -= l.w * x59; } { const v4f l = GDN_L4(62, 15); x62 -= l.x * x60; x62 -= l.y * x61; } __builtin_amdgcn_sched_barrier(0);
        float x63 = GDN_RHS(63); { const v4f l = GDN_L4(63, 0); x63 -= l.x * x0; x63 -= l.y * x1; x63 -= l.z * x2; x63 -= l.w * x3; } { const v4f l = GDN_L4(63, 1); x63 -= l.x * x4; x63 -= l.y * x5; x63 -= l.z * x6; x63 -= l.w * x7; } { const v4f l = GDN_L4(63, 2); x63 -= l.x * x8; x63 -= l.y * x9; x63 -= l.z * x10; x63 -= l.w * x11; } { const v4f l = GDN_L4(63, 3); x63 -= l.x * x12; x63 -= l.y * x13; x63 -= l.z * x14; x63 -= l.w * x15; } { const v4f l = GDN_L4(63, 4); x63 -= l.x * x16; x63 -= l.y * x17; x63 -= l.z * x18; x63 -= l.w * x19; } { const v4f l = GDN_L4(63, 5); x63 -= l.x * x20; x63 -= l.y * x21; x63 -= l.z * x22; x63 -= l.w * x23; } { const v4f l = GDN_L4(63, 6); x63 -= l.x * x24; x63 -= l.y * x25; x63 -= l.z * x26; x63 -= l.w * x27; } { const v4f l = GDN_L4(63, 7); x63 -= l.x * x28; x63 -= l.y * x29; x63 -= l.z * x30; x63 -= l.w * x31; } { const v4f l = GDN_L4(63, 8); x63 -= l.x * x32; x63 -= l.y * x33; x63 -= l.z * x34; x63 -= l.w * x35; } { const v4f l = GDN_L4(63, 9); x63 -= l.x * x36; x63 -= l.y * x37; x63 -= l.z * x38; x63 -= l.w * x39; } { const v4f l = GDN_L4(63, 10); x63 -= l.x * x40; x63 -= l.y * x41; x63 -= l.z * x42; x63 -= l.w * x43; } { const v4f l = GDN_L4(63, 11); x63 -= l.x * x44; x63 -= l.y * x45; x63 -= l.z * x46; x63 -= l.w * x47; } { const v4f l = GDN_L4(63, 12); x63 -= l.x * x48; x63 -= l.y * x49; x63 -= l.z * x50; x63 -= l.w * x51; } { const v4f l = GDN_L4(63, 13); x63 -= l.x * x52; x63 -= l.y * x53; x63 -= l.z * x54; x63 -= l.w * x55; } { const v4f l = GDN_L4(63, 14); x63 -= l.x * x56; x63 -= l.y * x57; x63 -= l.z * x58; x63 -= l.w * x59; } { const v4f l = GDN_L4(63, 15); x63 -= l.x * x60; x63 -= l.y * x61; x63 -= l.z * x62; } __builtin_amdgcn_sched_barrier(0);
        if (c < 128) { GU[0 * 128 + c] = x0; GU[1 * 128 + c] = x1; GU[2 * 128 + c] = x2; GU[3 * 128 + c] = x3; GU[4 * 128 + c] = x4; GU[5 * 128 + c] = x5; GU[6 * 128 + c] = x6; GU[7 * 128 + c] = x7; GU[8 * 128 + c] = x8; GU[9 * 128 + c] = x9; GU[10 * 128 + c] = x10; GU[11 * 128 + c] = x11; GU[12 * 128 + c] = x12; GU[13 * 128 + c] = x13; GU[14 * 128 + c] = x14; GU[15 * 128 + c] = x15; GU[16 * 128 + c] = x16; GU[17 * 128 + c] = x17; GU[18 * 128 + c] = x18; GU[19 * 128 + c] = x19; GU[20 * 128 + c] = x20; GU[21 * 128 + c] = x21; GU[22 * 128 + c] = x22; GU[23 * 128 + c] = x23; GU[24 * 128 + c] = x24; GU[25 * 128 + c] = x25; GU[26 * 128 + c] = x26; GU[27 * 128 + c] = x27; GU[28 * 128 + c] = x28; GU[29 * 128 + c] = x29; GU[30 * 128 + c] = x30; GU[31 * 128 + c] = x31; GU[32 * 128 + c] = x32; GU[33 * 128 + c] = x33; GU[34 * 128 + c] = x34; GU[35 * 128 + c] = x35; GU[36 * 128 + c] = x36; GU[37 * 128 + c] = x37; GU[38 * 128 + c] = x38; GU[39 * 128 + c] = x39; GU[40 * 128 + c] = x40; GU[41 * 128 + c] = x41; GU[42 * 128 + c] = x42; GU[43 * 128 + c] = x43; GU[44 * 128 + c] = x44; GU[45 * 128 + c] = x45; GU[46 * 128 + c] = x46; GU[47 * 128 + c] = x47; GU[48 * 128 + c] = x48; GU[49 * 128 + c] = x49; GU[50 * 128 + c] = x50; GU[51 * 128 + c] = x51; GU[52 * 128 + c] = x52; GU[53 * 128 + c] = x53; GU[54 * 128 + c] = x54; GU[55 * 128 + c] = x55; GU[56 * 128 + c] = x56; GU[57 * 128 + c] = x57; GU[58 * 128 + c] = x58; GU[59 * 128 + c] = x59; GU[60 * 128 + c] = x60; GU[61 * 128 + c] = x61; GU[62 * 128 + c] = x62; GU[63 * 128 + c] = x63; }
        else { GNW[0 * 128 + (c - 128)] = (bf16)f2bf(-x0); GNW[1 * 128 + (c - 128)] = (bf16)f2bf(-x1); GNW[2 * 128 + (c - 128)] = (bf16)f2bf(-x2); GNW[3 * 128 + (c - 128)] = (bf16)f2bf(-x3); GNW[4 * 128 + (c - 128)] = (bf16)f2bf(-x4); GNW[5 * 128 + (c - 128)] = (bf16)f2bf(-x5); GNW[6 * 128 + (c - 128)] = (bf16)f2bf(-x6); GNW[7 * 128 + (c - 128)] = (bf16)f2bf(-x7); GNW[8 * 128 + (c - 128)] = (bf16)f2bf(-x8); GNW[9 * 128 + (c - 128)] = (bf16)f2bf(-x9); GNW[10 * 128 + (c - 128)] = (bf16)f2bf(-x10); GNW[11 * 128 + (c - 128)] = (bf16)f2bf(-x11); GNW[12 * 128 + (c - 128)] = (bf16)f2bf(-x12); GNW[13 * 128 + (c - 128)] = (bf16)f2bf(-x13); GNW[14 * 128 + (c - 128)] = (bf16)f2bf(-x14); GNW[15 * 128 + (c - 128)] = (bf16)f2bf(-x15); GNW[16 * 128 + (c - 128)] = (bf16)f2bf(-x16); GNW[17 * 128 + (c - 128)] = (bf16)f2bf(-x17); GNW[18 * 128 + (c - 128)] = (bf16)f2bf(-x18); GNW[19 * 128 + (c - 128)] = (bf16)f2bf(-x19); GNW[20 * 128 + (c - 128)] = (bf16)f2bf(-x20); GNW[21 * 128 + (c - 128)] = (bf16)f2bf(-x21); GNW[22 * 128 + (c - 128)] = (bf16)f2bf(-x22); GNW[23 * 128 + (c - 128)] = (bf16)f2bf(-x23); GNW[24 * 128 + (c - 128)] = (bf16)f2bf(-x24); GNW[25 * 128 + (c - 128)] = (bf16)f2bf(-x25); GNW[26 * 128 + (c - 128)] = (bf16)f2bf(-x26); GNW[27 * 128 + (c - 128)] = (bf16)f2bf(-x27); GNW[28 * 128 + (c - 128)] = (bf16)f2bf(-x28); GNW[29 * 128 + (c - 128)] = (bf16)f2bf(-x29); GNW[30 * 128 + (c - 128)] = (bf16)f2bf(-x30); GNW[31 * 128 + (c - 128)] = (bf16)f2bf(-x31); GNW[32 * 128 + (c - 128)] = (bf16)f2bf(-x32); GNW[33 * 128 + (c - 128)] = (bf16)f2bf(-x33); GNW[34 * 128 + (c - 128)] = (bf16)f2bf(-x34); GNW[35 * 128 + (c - 128)] = (bf16)f2bf(-x35); GNW[36 * 128 + (c - 128)] = (bf16)f2bf(-x36); GNW[37 * 128 + (c - 128)] = (bf16)f2bf(-x37); GNW[38 * 128 + (c - 128)] = (bf16)f2bf(-x38); GNW[39 * 128 + (c - 128)] = (bf16)f2bf(-x39); GNW[40 * 128 + (c - 128)] = (bf16)f2bf(-x40); GNW[41 * 128 + (c - 128)] = (bf16)f2bf(-x41); GNW[42 * 128 + (c - 128)] = (bf16)f2bf(-x42); GNW[43 * 128 + (c - 128)] = (bf16)f2bf(-x43); GNW[44 * 128 + (c - 128)] = (bf16)f2bf(-x44); GNW[45 * 128 + (c - 128)] = (bf16)f2bf(-x45); GNW[46 * 128 + (c - 128)] = (bf16)f2bf(-x46); GNW[47 * 128 + (c - 128)] = (bf16)f2bf(-x47); GNW[48 * 128 + (c - 128)] = (bf16)f2bf(-x48); GNW[49 * 128 + (c - 128)] = (bf16)f2bf(-x49); GNW[50 * 128 + (c - 128)] = (bf16)f2bf(-x50); GNW[51 * 128 + (c - 128)] = (bf16)f2bf(-x51); GNW[52 * 128 + (c - 128)] = (bf16)f2bf(-x52); GNW[53 * 128 + (c - 128)] = (bf16)f2bf(-x53); GNW[54 * 128 + (c - 128)] = (bf16)f2bf(-x54); GNW[55 * 128 + (c - 128)] = (bf16)f2bf(-x55); GNW[56 * 128 + (c - 128)] = (bf16)f2bf(-x56); GNW[57 * 128 + (c - 128)] = (bf16)f2bf(-x57); GNW[58 * 128 + (c - 128)] = (bf16)f2bf(-x58); GNW[59 * 128 + (c - 128)] = (bf16)f2bf(-x59); GNW[60 * 128 + (c - 128)] = (bf16)f2bf(-x60); GNW[61 * 128 + (c - 128)] = (bf16)f2bf(-x61); GNW[62 * 128 + (c - 128)] = (bf16)f2bf(-x62); GNW[63 * 128 + (c - 128)] = (bf16)f2bf(-x63); }
#undef GDN_RHS
#undef GDN_L4
    } else {
        const int t2 = tid - 256; const float gl = gcs[63];
        { const int i = t2 >> 2, d0 = (t2 & 3) * 32; const float e = __expf(gcs[i]);
#pragma unroll
          for (int x8 = 0; x8 < 4; ++x8) { const v4f a = *(const LAS v4f*)(qs + i * QP + d0 + 8 * x8), b = *(const LAS v4f*)(qs + i * QP + d0 + 8 * x8 + 4);
              v4u w; w.x = pk2(a.x * e, a.y * e); w.y = pk2(a.z * e, a.w * e); w.z = pk2(b.x * e, b.y * e); w.w = pk2(b.z * e, b.w * e); *(v4u*)(GQG + i * 128 + d0 + 8 * x8) = w; } }
        { const int d = t2 >> 1, j0 = (t2 & 1) * 32;
#pragma unroll
          for (int x8 = 0; x8 < 4; ++x8) { float o[8];
#pragma unroll
              for (int x = 0; x < 8; ++x) { const int j = j0 + 8 * x8 + x; o[x] = ks[j * QP + d] * __expf(gl - gcs[j]); }
              v4u w; w.x = pk2(o[0], o[1]); w.y = pk2(o[2], o[3]); w.z = pk2(o[4], o[5]); w.w = pk2(o[6], o[7]); *(v4u*)(GKT + d * 64 + j0 + 8 * x8) = w; } }
        if (t2 == 0) GDL[item] = __expf(gl);
    }
    __syncthreads();
}
struct GdnFrags { bf16x8_t nw[4], qg[4], at[2], kt[2][2]; float u[4]; float dl; };
__device__ __forceinline__ void gdn_load(GdnFrags& F, const Params& p, int item, int off128, int off64, int offk, int offu) {
    const bf16* GNW = (const bf16*)(p.ws + WS_GNW) + (size_t)item * 8192; const bf16* GQG = (const bf16*)(p.ws + WS_GQG) + (size_t)item * 8192;
    const bf16* GAT = (const bf16*)(p.ws + WS_GAT) + (size_t)item * 4096; const bf16* GKT = (const bf16*)(p.ws + WS_GKT) + (size_t)item * 8192; const float* GU = (const float*)(p.ws + WS_GU) + (size_t)item * 8192;
#pragma unroll
    for (int ks = 0; ks < 4; ++ks) { F.nw[ks] = *(const bf16x8_t*)(GNW + off128 + 32 * ks); F.qg[ks] = *(const bf16x8_t*)(GQG + off128 + 32 * ks); }
#pragma unroll
    for (int ks = 0; ks < 2; ++ks) { F.at[ks] = *(const bf16x8_t*)(GAT + off64 + 32 * ks); F.kt[0][ks] = *(const bf16x8_t*)(GKT + offk + 32 * ks); F.kt[1][ks] = *(const bf16x8_t*)(GKT + offk + 1024 + 32 * ks); }
#pragma unroll
    for (int r = 0; r < 4; ++r) F.u[r] = GU[offu + r * 128];
    F.dl = ((const float*)(p.ws + WS_GDL))[item];
}
constexpr int STP = 136, VNP = 72;
__device__ __forceinline__ void gdn_seq(const Params& p, LAS unsigned char* lds, int wgi, int wave, int lane) {
    const int u = wgi * 2 + (wave >> 2), wi = wave & 3, h = u >> 3, sl = u & 7, g = lane >> 4, c = lane & 15;
    LAS unsigned short* ST = (LAS unsigned short*)(lds + (wave >> 2) * 12288);
    LAS unsigned short* VNT = ST + 2 * 16 * STP;
    float* GO = (float*)(p.ws + WS_GO);
    const int off128 = (16 * wi + c) * 128 + 8 * g, off64 = (16 * wi + c) * 64 + 8 * g, offk = (32 * wi + c) * 64 + 8 * g, offu = (16 * wi + 4 * g) * 128 + 16 * sl + c;
#pragma unroll
    for (int mt = 0; mt < 2; ++mt) *(LAS v2u*)(ST + c * STP + 16 * (2 * wi + mt) + 4 * g) = (v2u){0u, 0u};
    pg8::f32x4 Sacc[2] = {{0.f, 0.f, 0.f, 0.f}, {0.f, 0.f, 0.f, 0.f}};
    __syncthreads();
    GdnFrags F0, F1;
    gdn_load(F0, p, h, off128, off64, offk, offu);
#define GDN_STEP(F, n_) do { const int cur = (n_) & 1; bf16x8_t sf[4]; \
        _Pragma("unroll") for (int ks = 0; ks < 4; ++ks) sf[ks] = *(const LAS bf16x8_t*)(ST + cur * 16 * STP + c * STP + 32 * ks + 8 * g); \
        pg8::f32x4 vn = {F.u[0], F.u[1], F.u[2], F.u[3]}; \
        _Pragma("unroll") for (int ks = 0; ks < 4; ++ks) vn = __builtin_amdgcn_mfma_f32_16x16x32_bf16(F.nw[ks], sf[ks], vn, 0, 0, 0); \
        { v2u w; w.x = pk2(vn[0], vn[1]); w.y = pk2(vn[2], vn[3]); *(LAS v2u*)(VNT + c * VNP + 16 * wi + 4 * g) = w; } \
        LDS_BAR(); \
        const bf16x8_t v0 = *(const LAS bf16x8_t*)(VNT + c * VNP + 8 * g), v1 = *(const LAS bf16x8_t*)(VNT + c * VNP + 32 + 8 * g); \
        pg8::f32x4 o = {0.f, 0.f, 0.f, 0.f}; \
        _Pragma("unroll") for (int ks = 0; ks < 4; ++ks) o = __builtin_amdgcn_mfma_f32_16x16x32_bf16(F.qg[ks], sf[ks], o, 0, 0, 0); \
        o = __builtin_amdgcn_mfma_f32_16x16x32_bf16(F.at[0], v0, o, 0, 0, 0); o = __builtin_amdgcn_mfma_f32_16x16x32_bf16(F.at[1], v1, o, 0, 0, 0); \
        { const size_t tb = (size_t)(n_) * 64 + 16 * wi + 4 * g; _Pragma("unroll") for (int r = 0; r < 4; ++r) GO[(tb + r) * BW + h * 128 + 16 * sl + c] = o[r]; } \
        _Pragma("unroll") for (int mt = 0; mt < 2; ++mt) { Sacc[mt] = Sacc[mt] * F.dl; \
            Sacc[mt] = __builtin_amdgcn_mfma_f32_16x16x32_bf16(F.kt[mt][0], v0, Sacc[mt], 0, 0, 0); Sacc[mt] = __builtin_amdgcn_mfma_f32_16x16x32_bf16(F.kt[mt][1], v1, Sacc[mt], 0, 0, 0); \
            v2u w; w.x = pk2(Sacc[mt][0], Sacc[mt][1]); w.y = pk2(Sacc[mt][2], Sacc[mt][3]); *(LAS v2u*)(ST + (cur ^ 1) * 16 * STP + c * STP + 16 * (2 * wi + mt) + 4 * g) = w; } \
        LDS_BAR(); } while (0)
    for (int n = 0; n < T / 64; n += 2) {
        gdn_load(F1, p, (n + 1) * 4 + h, off128, off64, offk, offu);
        GDN_STEP(F0, n);
        gdn_load(F0, p, ((n + 2 < T / 64) ? n + 2 : n) * 4 + h, off128, off64, offk, offu);
        GDN_STEP(F1, n + 1);
    }
#undef GDN_STEP
}

constexpr int SEQ_UOFF = 132096;
constexpr int GI_NW = 0, GI_QG = 8704, GI_AT = 17408, GI_KT = 22016, GI_SZ = 31232;
struct GdnStage { v4u r[7]; float u[4]; float dl; };
__device__ __forceinline__ void gdn_stage_load(GdnStage& Sg, const Params& p, int item, int tid, int offu) {
    const bf16* GNW = (const bf16*)(p.ws + WS_GNW) + (size_t)item * 8192; const bf16* GQG = (const bf16*)(p.ws + WS_GQG) + (size_t)item * 8192;
    const bf16* GAT = (const bf16*)(p.ws + WS_GAT) + (size_t)item * 4096; const bf16* GKT = (const bf16*)(p.ws + WS_GKT) + (size_t)item * 8192; const float* GU = (const float*)(p.ws + WS_GU) + (size_t)item * 8192;
    Sg.r[0] = *(const v4u*)(GNW + 8 * tid); Sg.r[1] = *(const v4u*)(GNW + 8 * (tid + 512)); Sg.r[2] = *(const v4u*)(GQG + 8 * tid); Sg.r[3] = *(const v4u*)(GQG + 8 * (tid + 512));
    Sg.r[4] = *(const v4u*)(GAT + 8 * tid); Sg.r[5] = *(const v4u*)(GKT + 8 * tid); Sg.r[6] = *(const v4u*)(GKT + 8 * (tid + 512));
#pragma unroll
    for (int r = 0; r < 4; ++r) Sg.u[r] = GU[offu + r * 128];
    Sg.dl = ((const float*)(p.ws + WS_GDL))[item];
}
__device__ __forceinline__ void gdn_stage_write(const GdnStage& Sg, LAS unsigned short* img, int tid) {
    { const int p0 = tid, p1 = tid + 512;
      *(LAS v4u*)(img + GI_NW + (p0 >> 4) * 136 + 8 * (p0 & 15)) = Sg.r[0]; *(LAS v4u*)(img + GI_NW + (p1 >> 4) * 136 + 8 * (p1 & 15)) = Sg.r[1];
      *(LAS v4u*)(img + GI_QG + (p0 >> 4) * 136 + 8 * (p0 & 15)) = Sg.r[2]; *(LAS v4u*)(img + GI_QG + (p1 >> 4) * 136 + 8 * (p1 & 15)) = Sg.r[3];
      *(LAS v4u*)(img + GI_AT + (p0 >> 3) * 72 + 8 * (p0 & 7)) = Sg.r[4];
      *(LAS v4u*)(img + GI_KT + (p0 >> 3) * 72 + 8 * (p0 & 7)) = Sg.r[5]; *(LAS v4u*)(img + GI_KT + (p1 >> 3) * 72 + 8 * (p1 & 7)) = Sg.r[6]; }
}
__device__ __forceinline__ void gdn_seq2(const Params& p, LAS unsigned char* lds, int wgi, int tid, int wave, int lane) {
    const int h = wgi >> 2, sl = 2 * (wgi & 3) + (wave >> 2), wi = wave & 3, g = lane >> 4, c = lane & 15;
    LAS unsigned short* IMG = (LAS unsigned short*)lds;
    LAS unsigned short* ST = (LAS unsigned short*)(lds + SEQ_UOFF + (wave >> 2) * 12288);
    LAS unsigned short* VNT = ST + 2 * 16 * STP;
    float* GO = (float*)(p.ws + WS_GO);
    const int offu = (16 * wi + 4 * g) * 128 + 16 * sl + c;
#pragma unroll
    for (int mt = 0; mt < 2; ++mt) *(LAS v2u*)(ST + c * STP + 16 * (2 * wi + mt) + 4 * g) = (v2u){0u, 0u};
    pg8::f32x4 Sacc[2] = {{0.f, 0.f, 0.f, 0.f}, {0.f, 0.f, 0.f, 0.f}};
    GdnStage A, B;
    gdn_stage_load(A, p, h, tid, offu); gdn_stage_write(A, IMG, tid);
    gdn_stage_load(B, p, 4 + h, tid, offu);
    LDS_BAR();
    constexpr int NCH = T / 64;
#define GDN_STEP2(X, Y, n_) do { const int cur = (n_) & 1; const LAS unsigned short* im = IMG + cur * GI_SZ; bf16x8_t sf[4]; \
        _Pragma("unroll") for (int ks = 0; ks < 4; ++ks) sf[ks] = *(const LAS bf16x8_t*)(ST + cur * 16 * STP + c * STP + 32 * ks + 8 * g); \
        pg8::f32x4 vn = {X.u[0], X.u[1], X.u[2], X.u[3]}; const float dl = X.dl; \
        _Pragma("unroll") for (int ks = 0; ks < 4; ++ks) vn = __builtin_amdgcn_mfma_f32_16x16x32_bf16(*(const LAS bf16x8_t*)(im + GI_NW + (16 * wi + c) * 136 + 32 * ks + 8 * g), sf[ks], vn, 0, 0, 0); \
        { v2u w; w.x = pk2(vn[0], vn[1]); w.y = pk2(vn[2], vn[3]); *(LAS v2u*)(VNT + c * VNP + 16 * wi + 4 * g) = w; } \
        pg8::f32x4 o = {0.f, 0.f, 0.f, 0.f}; \
        _Pragma("unroll") for (int ks = 0; ks < 4; ++ks) o = __builtin_amdgcn_mfma_f32_16x16x32_bf16(*(const LAS bf16x8_t*)(im + GI_QG + (16 * wi + c) * 136 + 32 * ks + 8 * g), sf[ks], o, 0, 0, 0); \
        LDS_BAR(); \
        gdn_stage_load(X, p, (((n_) + 2 < NCH) ? (n_) + 2 : (n_)) * 4 + h, tid, offu); \
        const bf16x8_t v0 = *(const LAS bf16x8_t*)(VNT + c * VNP + 8 * g), v1 = *(const LAS bf16x8_t*)(VNT + c * VNP + 32 + 8 * g); \
        o = __builtin_amdgcn_mfma_f32_16x16x32_bf16(*(const LAS bf16x8_t*)(im + GI_AT + (16 * wi + c) * 72 + 8 * g), v0, o, 0, 0, 0); \
        o = __builtin_amdgcn_mfma_f32_16x16x32_bf16(*(const LAS bf16x8_t*)(im + GI_AT + (16 * wi + c) * 72 + 32 + 8 * g), v1, o, 0, 0, 0); \
        { const size_t tb = (size_t)(n_) * 64 + 16 * wi + 4 * g; _Pragma("unroll") for (int r = 0; r < 4; ++r) GO[(tb + r) * BW + h * 128 + 16 * sl + c] = o[r]; } \
        _Pragma("unroll") for (int mt = 0; mt < 2; ++mt) { Sacc[mt] = Sacc[mt] * dl; \
            Sacc[mt] = __builtin_amdgcn_mfma_f32_16x16x32_bf16(*(const LAS bf16x8_t*)(im + GI_KT + (16 * (2 * wi + mt) + c) * 72 + 8 * g), v0, Sacc[mt], 0, 0, 0); \
            Sacc[mt] = __builtin_amdgcn_mfma_f32_16x16x32_bf16(*(const LAS bf16x8_t*)(im + GI_KT + (16 * (2 * wi + mt) + c) * 72 + 32 + 8 * g), v1, Sacc[mt], 0, 0, 0); \
            v2u w; w.x = pk2(Sacc[mt][0], Sacc[mt][1]); w.y = pk2(Sacc[mt][2], Sacc[mt][3]); *(LAS v2u*)(ST + (cur ^ 1) * 16 * STP + c * STP + 16 * (2 * wi + mt) + 4 * g) = w; } \
        gdn_stage_write(Y, IMG + (cur ^ 1) * GI_SZ, tid); \
        LDS_BAR(); } while (0)
    for (int n = 0; n < NCH; n += 2) { GDN_STEP2(A, B, n); GDN_STEP2(B, A, n + 1); }
#undef GDN_STEP2
}
constexpr int MI_Q = 0, MI_S = 4608, MI_K = 9216, MI_SZ = 13824;
struct MlStage { v4u r[3]; bf16x8_t vt[2]; float fl; };
__device__ __forceinline__ void ml_stage_load(MlStage& Sg, const Params& p, int item, int tid, int offV) {
    const bf16* MQ = (const bf16*)(p.ws + WS_MQ) + (size_t)item * 4096; const bf16* MS = (const bf16*)(p.ws + WS_MS) + (size_t)item * 4096; const bf16* MK = (const bf16*)(p.ws + WS_MK) + (size_t)item * 4096;
    const bf16* MV = (const bf16*)(p.ws + WS_MV) + (size_t)item * 9216;
    Sg.r[0] = *(const v4u*)(MQ + 8 * tid); Sg.r[1] = *(const v4u*)(MS + 8 * tid); Sg.r[2] = *(const v4u*)(MK + 8 * tid);
    Sg.vt[0] = *(const bf16x8_t*)(MV + offV); Sg.vt[1] = *(const bf16x8_t*)(MV + offV + 32);
    Sg.fl = ((const float*)(p.ws + WS_MFL))[item];
}
__device__ __forceinline__ void ml_stage_write(const MlStage& Sg, LAS unsigned short* img, int tid) {
    const int o = (tid >> 3) * 72 + 8 * (tid & 7);
    *(LAS v4u*)(img + MI_Q + o) = Sg.r[0]; *(LAS v4u*)(img + MI_S + o) = Sg.r[1]; *(LAS v4u*)(img + MI_K + o) = Sg.r[2];
}
__device__ __forceinline__ void ml_seq2(const Params& p, LAS unsigned char* lds, int wgi, int tid, int wave, int lane) {
    const int h = wgi / 5, sl0 = 2 * (wgi % 5) + (wave >> 2), wi = wave & 3, g = lane >> 4, c = lane & 15;
    const bool real = sl0 < 9; const int sl = real ? sl0 : 8;
    LAS unsigned short* IMG = (LAS unsigned short*)lds;
    LAS unsigned short* CT = (LAS unsigned short*)(lds + SEQ_UOFF + (wave >> 2) * 8192);
    float* HO = (float*)(p.ws + WS_HO); float* HDEN = (float*)(p.ws + WS_HDEN);
    const int offV = (16 * sl + c) * 64 + 8 * g;
    *(LAS v2u*)(CT + c * 72 + 16 * wi + 4 * g) = (v2u){0u, 0u};
    pg8::f32x4 Cacc = {0.f, 0.f, 0.f, 0.f};
    MlStage A, B;
    ml_stage_load(A, p, h, tid, offV); ml_stage_write(A, IMG, tid);
    ml_stage_load(B, p, 4 + h, tid, offV);
    LDS_BAR();
    constexpr int NCH = T / 64;
#define ML_STEP2(X, Y, n_) do { const int cur = (n_) & 1; const LAS unsigned short* im = IMG + cur * MI_SZ; const int ro = (16 * wi + c) * 72 + 8 * g; \
        const bf16x8_t c0 = *(const LAS bf16x8_t*)(CT + cur * 16 * 72 + c * 72 + 8 * g), c1 = *(const LAS bf16x8_t*)(CT + cur * 16 * 72 + c * 72 + 32 + 8 * g); \
        const bf16x8_t vt0 = X.vt[0], vt1 = X.vt[1]; const float fl = X.fl; \
        pg8::f32x4 num = {0.f, 0.f, 0.f, 0.f}; \
        num = __builtin_amdgcn_mfma_f32_16x16x32_bf16(*(const LAS bf16x8_t*)(im + MI_Q + ro), c0, num, 0, 0, 0); num = __builtin_amdgcn_mfma_f32_16x16x32_bf16(*(const LAS bf16x8_t*)(im + MI_Q + ro + 32), c1, num, 0, 0, 0); \
        num = __builtin_amdgcn_mfma_f32_16x16x32_bf16(*(const LAS bf16x8_t*)(im + MI_S + ro), vt0, num, 0, 0, 0); num = __builtin_amdgcn_mfma_f32_16x16x32_bf16(*(const LAS bf16x8_t*)(im + MI_S + ro + 32), vt1, num, 0, 0, 0); \
        Cacc = Cacc * fl; \
        Cacc = __builtin_amdgcn_mfma_f32_16x16x32_bf16(*(const LAS bf16x8_t*)(im + MI_K + ro), vt0, Cacc, 0, 0, 0); Cacc = __builtin_amdgcn_mfma_f32_16x16x32_bf16(*(const LAS bf16x8_t*)(im + MI_K + ro + 32), vt1, Cacc, 0, 0, 0); \
        ml_stage_load(X, p, (((n_) + 2 < NCH) ? (n_) + 2 : (n_)) * 4 + h, tid, offV); \
        { v2u w; w.x = pk2(Cacc[0], Cacc[1]); w.y = pk2(Cacc[2], Cacc[3]); *(LAS v2u*)(CT + (cur ^ 1) * 16 * 72 + c * 72 + 16 * wi + 4 * g) = w; } \
        { const size_t tb = (size_t)(n_) * 64 + 16 * wi + 4 * g; \
          if (sl < 8) { _Pragma("unroll") for (int r = 0; r < 4; ++r) HO[(tb + r) * BW + h * 128 + 16 * sl + c] = num[r]; } \
          else if (c == 0 && real) { _Pragma("unroll") for (int r = 0; r < 4; ++r) HDEN[(tb + r) * 4 + h] = num[r]; } } \
        ml_stage_write(Y, IMG + (cur ^ 1) * MI_SZ, tid); \
        LDS_BAR(); } while (0)
    for (int n = 0; n < NCH; n += 2) { ML_STEP2(A, B, n); ML_STEP2(B, A, n + 1); }
#undef ML_STEP2
}

__device__ __forceinline__ void mixer_gmlp_item(const Params& p, int l, LAS unsigned char* lds, int item, int tid, int wave, int lane) {
    const int chunk = item >> 2, g = item & 3; const size_t tok0 = (size_t)chunk * 128;
    const bf16* Z = (const bf16*)(p.ws + WS_Z); bf16* BR1 = (bf16*)(p.ws + WS_BR) + (size_t)1 * T * BW;
    const float* ng = p.in[I_GMNG] + l * BW; const float* nb = p.in[I_GMNB] + l * BW;
    const float* wsp = p.in[I_GMWS] + ((size_t)(l * 4 + g) * 128) * 128; const float* bsp = p.in[I_GMBS] + (l * 4 + g) * 128;
    LAS float* vn = (LAS float*)lds;
    for (int r = 0; r < 16; ++r) { const int tk = wave * 16 + r;
        const v4u raw = *(const v4u*)(Z + (tok0 + tk) * ZC + ZC_GMV + 8 * lane); float x[8]; unpack8(raw, x); float s = 0.f;
#pragma unroll
        for (int i = 0; i < 8; ++i) { x[i] = gelu_tanh(x[i]); s += x[i]; }
        const float mean = wave_sum(s) * (1.f / 512.f); float ss = 0.f;
#pragma unroll
        for (int i = 0; i < 8; ++i) { x[i] -= mean; ss += x[i] * x[i]; }
        const float rstd = rsqrtf(wave_sum(ss) * (1.f / 512.f) + LN_EPS);
        if ((lane >> 4) == g) { const int cl = 8 * (lane & 15);
#pragma unroll
            for (int i = 0; i < 8; ++i) vn[tk * 128 + cl + i] = x[i] * rstd * ng[8 * lane + i] + nb[8 * lane + i]; }
    }
    __syncthreads();
    const int t = tid >> 2, cq = tid & 3; float acc[32];
#pragma unroll
    for (int i = 0; i < 32; ++i) acc[i] = 0.f;
    const float* wrow = wsp + (size_t)t * 128;
    for (int s = 0; s <= t; ++s) { const float w = wrow[s]; const LAS float* row = vn + s * 128 + cq * 32;
#pragma unroll
        for (int i4 = 0; i4 < 8; ++i4) { const v4f a = *(const LAS v4f*)(row + 4 * i4); acc[4 * i4] += w * a.x; acc[4 * i4 + 1] += w * a.y; acc[4 * i4 + 2] += w * a.z; acc[4 * i4 + 3] += w * a.w; } }
    const float bias = bsp[t];
#pragma unroll
    for (int i8 = 0; i8 < 4; ++i8) { const v4u raw = *(const v4u*)(Z + (tok0 + t) * ZC + ZC_GMU + g * 128 + cq * 32 + 8 * i8); float u[8]; unpack8(raw, u); float o[8];
#pragma unroll
        for (int i = 0; i < 8; ++i) o[i] = gelu_tanh(u[i]) * (acc[8 * i8 + i] + bias);
        v4u w; w.x = pk2(o[0], o[1]); w.y = pk2(o[2], o[3]); w.z = pk2(o[4], o[5]); w.w = pk2(o[6], o[7]);
        *(v4u*)(BR1 + (tok0 + t) * BW + g * 128 + cq * 32 + 8 * i8) = w; }
    __syncthreads();
}

__device__ __forceinline__ void vt_item(const Params& p, LAS unsigned char* lds, int item, int tid) {
    const int h = item & 3, n = item >> 2; const size_t t0 = (size_t)n * 64;
    const bf16* Z = (const bf16*)(p.ws + WS_Z); bf16* VT = (bf16*)(p.ws + WS_VT);
    LAS unsigned short* vs = (LAS unsigned short*)lds;
#pragma unroll
    for (int r = 0; r < 2; ++r) { const int idx = tid + 512 * r, tk = idx >> 4, c8 = idx & 15;
        *(LAS v4u*)(vs + tk * 136 + 8 * c8) = *(const v4u*)(Z + (t0 + tk) * ZC + ZC_SBV + h * 128 + 8 * c8); }
    __syncthreads();
    { const int d = tid >> 2, jq = tid & 3; unsigned w[8];
#pragma unroll
      for (int x = 0; x < 8; ++x) w[x] = (unsigned)vs[(16 * jq + 2 * x) * 136 + d] | ((unsigned)vs[(16 * jq + 2 * x + 1) * 136 + d] << 16);
      bf16* dst = VT + ((size_t)h * 128 + d) * T + t0 + 16 * jq;
      *(v4u*)dst = (v4u){w[0], w[1], w[2], w[3]}; *(v4u*)(dst + 8) = (v4u){w[4], w[5], w[6], w[7]}; }
    __syncthreads();
}
constexpr int KTP = 136, VTP = 72;
__device__ __forceinline__ void sb_unit(const Params& p, LAS unsigned char* lds, int unit, int tid, int wave, int lane) {
    const int h = unit >> 6, q0 = (unit & 63) * 128, g = lane >> 4, c = lane & 15; const int qrow = q0 + 16 * wave + c;
    const bf16* Z = (const bf16*)(p.ws + WS_Z); const bf16* VT = (const bf16*)(p.ws + WS_VT) + (size_t)h * 128 * T; bf16* BR0 = (bf16*)(p.ws + WS_BR);
    LAS unsigned short* Kt = (LAS unsigned short*)lds;
    LAS unsigned short* Vt = Kt + 2 * 64 * KTP;
    LAS int* flags = (LAS int*)(Vt + 2 * 128 * VTP);
    bf16x8_t qf[4];
#pragma unroll
    for (int ks = 0; ks < 4; ++ks) qf[ks] = *(const bf16x8_t*)(Z + (size_t)qrow * ZC + ZC_SBQ + h * 128 + 32 * ks + 8 * g);
    pg8::f32x4 acc[8];
#pragma unroll
    for (int dt = 0; dt < 8; ++dt) acc[dt] = (pg8::f32x4){0.f, 0.f, 0.f, 0.f};
    float racc = 0.f;
    v4u kr[2], vr[2];
    const int jt = (q0 >> 6) + 1;
#define SB_GLOAD(j_) do { _Pragma("unroll") for (int r = 0; r < 2; ++r) { const int idx = tid + 512 * r; \
        kr[r] = *(const v4u*)(Z + (size_t)(64 * (j_) + (idx >> 4)) * ZC + ZC_SBK + h * 128 + 8 * (idx & 15)); \
        vr[r] = *(const v4u*)(VT + (size_t)(idx >> 3) * T + 64 * (j_) + 8 * (idx & 7)); } } while (0)
#define SB_LWRITE(b_) do { _Pragma("unroll") for (int r = 0; r < 2; ++r) { const int idx = tid + 512 * r; \
        *(LAS v4u*)(Kt + (b_) * 64 * KTP + (idx >> 4) * KTP + 8 * (idx & 15)) = kr[r]; *(LAS v4u*)(Vt + (b_) * 128 * VTP + (idx >> 3) * VTP + 8 * (idx & 7)) = vr[r]; } } while (0)
    LDS_BAR();
    SB_GLOAD(jt); SB_LWRITE(0);
    LDS_BAR();
    for (int j = jt, it = 0; j >= 0; --j, ++it) {
        const int cur = it & 1;
        SB_GLOAD(j > 0 ? j - 1 : 0);
        const bool wdone = __all(racc > 104.f);
        if (64 * j < q0 + 16 * wave + 15 && !wdone) {
            const LAS unsigned short* Kc = Kt + cur * 64 * KTP; const LAS unsigned short* Vc = Vt + cur * 128 * VTP;
            pg8::f32x4 z[4];
#pragma unroll
            for (int s = 0; s < 4; ++s) { z[s] = (pg8::f32x4){0.f, 0.f, 0.f, 0.f};
#pragma unroll
                for (int ks = 0; ks < 4; ++ks) z[s] = __builtin_amdgcn_mfma_f32_16x16x32_bf16(*(const LAS bf16x8_t*)(Kc + (16 * s + c) * KTP + 32 * ks + 8 * g), qf[ks], z[s], 0, 0, 0); }
            float sp[4][4], t[4], xs[4]; bool mk[4][4];
#pragma unroll
            for (int s = 0; s < 4; ++s) { t[s] = 0.f;
#pragma unroll
                for (int r = 0; r < 4; ++r) { const int key = 64 * j + 16 * s + 4 * g + r; mk[s][r] = key < qrow; const float zz = z[s][r] * 0.08838834764831845f; z[s][r] = zz;
                    sp[s][r] = mk[s][r] ? softplusf_(zz) : 0.f; t[s] += sp[s][r]; } }
            float grand = 0.f, higher[4];
#pragma unroll
            for (int s = 3; s >= 0; --s) { float x = t[s]; float y = __shfl(x, lane + 16); x += (g < 3) ? y : 0.f; y = __shfl(x, lane + 32); x += (g < 2) ? y : 0.f;
                xs[s] = x - t[s];
                const float tot = __shfl(x, c); higher[s] = grand; grand += tot; }
            bf16x8_t pf[2];
#pragma unroll
            for (int s = 0; s < 4; ++s) { float a[4]; float e = 0.f;
#pragma unroll
                for (int r = 3; r >= 0; --r) { const float la = z[s][r] - sp[s][r] - (racc + higher[s] + xs[s] + e); a[r] = mk[s][r] ? __expf(la) : 0.f; e += sp[s][r]; }
                const unsigned w0 = pk2(a[0], a[1]), w1 = pk2(a[2], a[3]);
                if ((s & 1) == 0) { pf[s >> 1][0] = (short)(w0 & 0xffff); pf[s >> 1][1] = (short)(w0 >> 16); pf[s >> 1][2] = (short)(w1 & 0xffff); pf[s >> 1][3] = (short)(w1 >> 16); }
                else              { pf[s >> 1][4] = (short)(w0 & 0xffff); pf[s >> 1][5] = (short)(w0 >> 16); pf[s >> 1][6] = (short)(w1 & 0xffff); pf[s >> 1][7] = (short)(w1 >> 16); } }
            racc += grand;
#pragma unroll
            for (int dt = 0; dt < 8; ++dt)
#pragma unroll
                for (int k2 = 0; k2 < 2; ++k2) { const v2u lo = *(const LAS v2u*)(Vc + (16 * dt + c) * VTP + 32 * k2 + 4 * g), hi = *(const LAS v2u*)(Vc + (16 * dt + c) * VTP + 32 * k2 + 16 + 4 * g);
                    const v4u vv = (v4u){lo.x, lo.y, hi.x, hi.y};
                    acc[dt] = __builtin_amdgcn_mfma_f32_16x16x32_bf16(__builtin_bit_cast(bf16x8_t, vv), pf[k2], acc[dt], 0, 0, 0); }
        }
        const bool wd2 = __all(racc > 104.f);
        if (lane == 0) flags[cur * 8 + wave] = wd2 ? 1 : 0;
        SB_LWRITE(cur ^ 1);
        LDS_BAR();
        int alld = 1;
#pragma unroll
        for (int w = 0; w < 8; ++w) alld &= flags[cur * 8 + w];
        if (alld) break;
    }
#undef SB_GLOAD
#undef SB_LWRITE
#pragma unroll
    for (int dt = 0; dt < 8; ++dt) { v2u w; w.x = pk2(acc[dt][0], acc[dt][1]); w.y = pk2(acc[dt][2], acc[dt][3]); *(v2u*)(BR0 + (size_t)qrow * BW + h * 128 + 16 * dt + 4 * g) = w; }
}

__device__ __forceinline__ void phase_mixers(const Params& p, int l, LAS unsigned char* lds, int wg, int G, int tid, int wave, int lane, const XcdBarrier& bar) {
#if defined(PROBE_SPLIT)
    if (wg < 16) gdn_seq2(p, lds, wg, tid, wave, lane); else if (wg < 36) ml_seq2(p, lds, wg - 16, tid, wave, lane);
    xcd_barrier(bar);
    const int w2 = wg, G2 = G;
#else
    if (wg < 16) { gdn_seq2(p, lds, wg, tid, wave, lane); return; }
    if (wg < 36) { ml_seq2(p, lds, wg - 16, tid, wave, lane); return; }
    const int w2 = wg - 36, G2 = G - 36;
#endif
    for (int it = w2; it < 256; it += G2) mixer_gmlp_item(p, l, lds, it, tid, wave, lane);
    for (int it = w2; it < 256; it += G2) sb_unit(p, lds, it, tid, wave, lane);
#if !defined(PROBE_CONV0)
    __syncthreads();
    phase_convert<1>(p, l, lds, w2 * 8 + wave, G2 * 8, wave, lane);
#endif
}

__device__ __forceinline__ void phase_post(const Params& p, int l, int gw, int NGW, int lane) {
    const bf16* Z = (const bf16*)(p.ws + WS_Z); const float* GO = (const float*)(p.ws + WS_GO); const float* HO = (const float*)(p.ws + WS_HO); const float* HDEN = (const float*)(p.ws + WS_HDEN);
    bf16* BR2 = (bf16*)(p.ws + WS_BR) + (size_t)2 * T * BW; bf16* BR3 = (bf16*)(p.ws + WS_BR) + (size_t)3 * T * BW;
    const float* gng = p.in[I_GDNNG] + l * 128; const float* mng = p.in[I_MLNG] + l * BW;
    for (int t = gw; t < T; t += NGW) {
        {   const v4f a0 = *(const v4f*)(GO + (size_t)t * BW + 8 * lane), a1 = *(const v4f*)(GO + (size_t)t * BW + 8 * lane + 4); float o[8] = {a0.x, a0.y, a0.z, a0.w, a1.x, a1.y, a1.z, a1.w}; float ss = 0.f;
#pragma unroll
            for (int i = 0; i < 8; ++i) ss += o[i] * o[i];
            const float r = rsqrtf(sum16(ss) * (1.f / 128.f) + LN_EPS);
            const v4u graw = *(const v4u*)(Z + (size_t)t * ZC + ZC_GDNG + 8 * lane); float gt[8]; unpack8(graw, gt);
#pragma unroll
            for (int i = 0; i < 8; ++i) o[i] = o[i] * r * gng[(8 * lane + i) & 127] * siluf_(gt[i]);
            v4u w; w.x = pk2(o[0], o[1]); w.y = pk2(o[2], o[3]); w.z = pk2(o[4], o[5]); w.w = pk2(o[6], o[7]); *(v4u*)(BR2 + (size_t)t * BW + 8 * lane) = w; }
        {   const v4f a0 = *(const v4f*)(HO + (size_t)t * BW + 8 * lane), a1 = *(const v4f*)(HO + (size_t)t * BW + 8 * lane + 4); float o[8] = {a0.x, a0.y, a0.z, a0.w, a1.x, a1.y, a1.z, a1.w}; float ss = 0.f;
            const float dn = 1.f / fmaxf(fabsf(HDEN[(size_t)t * 4 + (lane >> 4)]), 1.f);
#pragma unroll
            for (int i = 0; i < 8; ++i) { o[i] *= dn; ss += o[i] * o[i]; }
            const float r = rsqrtf(sum16(ss) * (1.f / 128.f) + LN_EPS);
            const v4u graw = *(const v4u*)(Z + (size_t)t * ZC + ZC_MLO + 8 * lane); float gt[8]; unpack8(graw, gt);
#pragma unroll
            for (int i = 0; i < 8; ++i) o[i] = o[i] * r * mng[8 * lane + i] * sigmoidf_(gt[i]);
            v4u w; w.x = pk2(o[0], o[1]); w.y = pk2(o[2], o[3]); w.z = pk2(o[4], o[5]); w.w = pk2(o[6], o[7]); *(v4u*)(BR3 + (size_t)t * BW + 8 * lane) = w; }
    }
}

__device__ __forceinline__ void ln_row(const float* yrow, const float* g, const float* b, int lane, v4f (&v)[8]) {
    const v4f* yr = (const v4f*)yrow + lane; float s = 0.f;
#pragma unroll
    for (int j = 0; j < 8; ++j) { v[j] = yr[64 * j]; s += (v[j].x + v[j].y) + (v[j].z + v[j].w); }
    const float mean = wave_sum(s) * (1.f / D); float s2 = 0.f;
#pragma unroll
    for (int j = 0; j < 8; ++j) { v[j] = v[j] - mean; s2 += (v[j].x * v[j].x + v[j].y * v[j].y) + (v[j].z * v[j].z + v[j].w * v[j].w); }
    const float rstd = rsqrtf(wave_sum(s2) * (1.f / D) + LN_EPS);
#pragma unroll
    for (int j = 0; j < 8; ++j) { const v4f gg = ((const v4f*)g)[lane + 64 * j], bb = ((const v4f*)b)[lane + 64 * j]; v[j] = v[j] * rstd * gg + bb; }
}
__device__ __forceinline__ void phase_ln1_router(const Params& p, int l, LAS unsigned char* lds, int wg, int G, int wave, int lane, int cnt_shift = 0) {
    const float* Y = (const float*)(p.ws + WS_Y); float* X1 = (float*)(p.ws + WS_X1); bf16* X1B = (bf16*)(p.ws + WS_X1B); int* LIST = (int*)(p.ws + WS_LIST); float* WL = (float*)(p.ws + WS_WL); unsigned* SLOT = (unsigned*)(p.ws + WS_SLOT);
    unsigned* cnt = (unsigned*)(p.ws + WS_CTL) + CW_CNT + l * 4096 + cnt_shift;
    const float* g1 = p.in[I_LN1G] + (size_t)l * D; const float* b1 = p.in[I_LN1B] + (size_t)l * D;
    const float* wr = p.in[I_WR] + (size_t)l * D * NE; const float rbias = p.in[I_RB][l * NE + lane];
    LAS float* xt = (LAS float*)lds;
    LAS float* part = (LAS float*)(lds + 65536);
    LAS unsigned* selm = (LAS unsigned*)(lds + 65536 + 16384);
    LAS float* wtm = (LAS float*)(lds + 65536 + 16384 + 16640);
    LAS unsigned char* rkm = (LAS unsigned char*)(lds + 65536 + 16384 + 16640 + 16384);
    for (int tl = wg; tl < T / 8; tl += G) {
        const size_t m = (size_t)tl * 8 + wave;
        {   v4f v[8]; ln_row(Y + m * D, g1, b1, lane, v);
            v4f* xo = (v4f*)(X1 + m * D) + lane; v2u* xb = (v2u*)(X1B + m * D) + lane;
#pragma unroll
            for (int j = 0; j < 8; ++j) { xo[64 * j] = v[j]; v2u o; o.x = pk2(v[j].x, v[j].y); o.y = pk2(v[j].z, v[j].w); xb[64 * j] = o; *(LAS v4f*)(xt + wave * D + 4 * lane + 256 * j) = v[j]; } }
        __syncthreads();
        {   float acc[8];
#pragma unroll
            for (int r = 0; r < 8; ++r) acc[r] = 0.f;
#pragma unroll 8
            for (int d4 = 0; d4 < 64; ++d4) { const int d = wave * 256 + 4 * d4;
                const float w0 = wr[(size_t)(d + 0) * NE + lane], w1 = wr[(size_t)(d + 1) * NE + lane], w2 = wr[(size_t)(d + 2) * NE + lane], w3 = wr[(size_t)(d + 3) * NE + lane];
#pragma unroll
                for (int r = 0; r < 8; ++r) { const v4f xv = *(const LAS v4f*)(xt + r * D + d); acc[r] += xv.x * w0 + xv.y * w1 + xv.z * w2 + xv.w * w3; } }
#pragma unroll
            for (int r = 0; r < 8; ++r) part[(wave * 8 + r) * 64 + lane] = acc[r]; }
        __syncthreads();
        {   float logit = 0.f;
#pragma unroll
            for (int w = 0; w < 8; ++w) logit += part[(w * 8 + wave) * 64 + lane];
            const float s = sigmoidf_(logit), biased = s + rbias;
            const float m1 = max8(biased); const float li = (float)(lane & 7);
            const float first = min8(biased == m1 ? li : 8.f);
            const float m2 = max8(li == first ? -INFINITY : biased);
            const float gs = m1 + m2; const int myg = lane >> 3; int grank = 0;
#pragma unroll
            for (int g2 = 0; g2 < 8; ++g2) { const float o = __builtin_bit_cast(float, __builtin_amdgcn_readlane(__builtin_bit_cast(int, gs), g2 * 8)); grank += (o > gs || (o == gs && g2 < myg)) ? 1 : 0; }
            const float masked = grank < 4 ? biased : -INFINITY; int rank = 0;
#pragma unroll
            for (int e2 = 0; e2 < 64; ++e2) { const float o = __builtin_bit_cast(float, __builtin_amdgcn_readlane(__builtin_bit_cast(int, masked), e2)); rank += (o > masked || (o == masked && e2 < lane)) ? 1 : 0; }
            const float wsel = rank < 6 ? s : 0.f; const float tot = wave_sum(wsel);
            const int ri = ((tl - wg) / G) * 8 + wave;
            selm[ri * 64 + lane] = (rank < 6) ? 1u : 0u; rkm[ri * 64 + lane] = (unsigned char)rank; wtm[ri * 64 + lane] = wsel / tot * 2.5f; }
        __syncthreads();
    }
    const int nrows = ((T / 8 - wg + G - 1) / G) * 8;
    if (wave == 0) { unsigned n = 0;
        for (int r = 0; r < nrows; ++r) n += selm[r * 64 + lane];
        unsigned base = 0; if (n && !(PROBE_NOATOM && cnt_shift)) base = __hip_atomic_fetch_add(cnt + 64 * lane, n, __ATOMIC_RELAXED, __HIP_MEMORY_SCOPE_AGENT);
        selm[64 * 64 + lane] = base; }
    __syncthreads();
    for (int ri = wave; ri < nrows; ri += 8) { unsigned pos = selm[64 * 64 + lane];
        for (int r = 0; r < ri; ++r) pos += selm[r * 64 + lane];
        if (selm[ri * 64 + lane]) { const size_t m = (size_t)(wg + (ri >> 3) * G) * 8 + (ri & 7); const int rk = rkm[ri * 64 + lane];
            LIST[lane * T + pos] = (int)m; WL[lane * T + pos] = wtm[ri * 64 + lane]; SLOT[m * 8 + rk] = ((unsigned)lane << 16) | pos; } }
    __syncthreads();
}
__device__ __forceinline__ void phase_combine_ln2(const Params& p, int l, float* dst, int gw, int NGW, int lane) {
    const float* X1 = (const float*)(p.ws + WS_X1); const bf16* YE = (const bf16*)(p.ws + WS_YEXP); const unsigned* SLOT = (const unsigned*)(p.ws + WS_SLOT);
    const unsigned* cnt = (const unsigned*)(p.ws + WS_CTL) + CW_CNT + l * 4096;
    const float* g2 = p.in[I_LN2G] + (size_t)l * D; const float* b2 = p.in[I_LN2B] + (size_t)l * D;
    const int tiles = ((int)cnt[64 * lane] + 255) >> 8; const float incl = wave_scan_incl((float)tiles);
    const int toff = (int)incl - tiles;
    const int tsh = __builtin_amdgcn_readlane((int)incl, 63);
    for (int m = gw; m < T; m += NGW) {
        v4f v[8]; const v4f* xr = (const v4f*)(X1 + (size_t)m * D) + lane;
#pragma unroll
        for (int j = 0; j < 8; ++j) v[j] = xr[64 * j] * ALPHA;
#pragma unroll
        for (int k = 0; k < 7; ++k) { size_t row;
            if (k == 0) row = (size_t)tsh * 256 + m;
            else { const unsigned s = __builtin_amdgcn_readfirstlane(SLOT[(size_t)m * 8 + (k - 1)]); const int e = (int)(s >> 16); row = (size_t)__builtin_amdgcn_readlane(toff, e) * 256 + (s & 0xffffu); }
            const v2u* yr = (const v2u*)(YE + row * D) + lane;
#pragma unroll
            for (int j = 0; j < 8; ++j) { const v2u y = yr[64 * j]; v[j].x += bflo(y.x); v[j].y += bfhi(y.x); v[j].z += bflo(y.y); v[j].w += bfhi(y.y); } }
        float s = 0.f;
#pragma unroll
        for (int j = 0; j < 8; ++j) s += (v[j].x + v[j].y) + (v[j].z + v[j].w);
        const float mean = wave_sum(s) * (1.f / D); float s2 = 0.f;
#pragma unroll
        for (int j = 0; j < 8; ++j) { v[j] = v[j] - mean; s2 += (v[j].x * v[j].x + v[j].y * v[j].y) + (v[j].z * v[j].z + v[j].w * v[j].w); }
        const float rstd = rsqrtf(wave_sum(s2) * (1.f / D) + LN_EPS);
        v4f* xo = (v4f*)(dst + (size_t)m * D) + lane;
#pragma unroll
        for (int j = 0; j < 8; ++j) { const v4f gg = ((const v4f*)g2)[lane + 64 * j], bb = ((const v4f*)b2)[lane + 64 * j]; xo[64 * j] = v[j] * rstd * gg + bb; }
    }
}

constexpr int NPH = 11;
template <class S> struct DupOrder {
    S s; int n;
    __device__ __forceinline__ bool next(int i, Unit& u) const { return s.next(i >= n ? i - n : i, u); }
    __device__ __forceinline__ int row_token(int i, int r) const { return s.row_token(i >= n ? i - n : i, r); }
    __device__ __forceinline__ void a_ready(const Unit& u) const { s.a_ready(u); }
    __device__ __forceinline__ void done(const Unit& u) const { s.done(u); }
};
template <class S> __device__ __forceinline__ int count_units(const S& s) { Unit u; int n = 0; while (n < 64 && s.next(n, u)) ++n; return n; }
#define ORDER_T(k, T) typename std::conditional<PROBE_DUP == (k), DupOrder<T>, T>::type
template <class S> __device__ __forceinline__ DupOrder<S> make_order(const S& s, std::true_type) { DupOrder<S> d{s, count_units(s)}; d.n = count_units(s); return d; }
template <class S> __device__ __forceinline__ S make_order(const S& s, std::false_type) { return s; }
#define MAKE_ORDER(k, s) make_order(s, std::integral_constant<bool, PROBE_DUP == (k)>())
template <int l>
__device__ __forceinline__ void run_layer(const Params& p, LAS unsigned char* lds, const XcdBarrier& bar, int tid, int lane, int wave, int G, int wg, int gw, int NGW) {
    unsigned char* ws = p.ws;
    {
        const float* xin = (l == 0) ? p.in[I_X] : (const float*)(ws + WS_XCUR);
        float* xout = (l == NL - 1) ? p.out : (float*)(ws + WS_XCUR);
#ifndef PROBE_DUP
#define PROBE_DUP (-1)
#endif
#define IS_GEMM_PH(k) ((k) == 1 || (k) == 5 || (k) == 6 || (k) == 8 || (k) == 9)
#define REP(k) _Pragma("nounroll") for (int _r = 0; _r < ((PROBE_DUP == (k) && !IS_GEMM_PH(k)) ? 2 + (p.ph_lo >> 20) : 1); ++_r)
#ifndef PH_MASK
#define PH_MASK 0x7ff
#endif
#define RUN(k) (((PH_MASK >> (k)) & 1) && p.ph_lo <= l * NPH + (k) && l * NPH + (k) < p.ph_hi)
#define SEAM(k) do { if (l * NPH + (k) + 1 < p.ph_hi) xcd_barrier(bar); } while (0)
        if (RUN(0)) { REP(0) { phase_convert<0>(p, l, lds, gw, NGW, wave, lane);
#if defined(PROBE_CONV0)
            phase_convert<1>(p, l, lds, gw, NGW, wave, lane);
#endif
 phase_xprep(p, l, xin, lds, gw, NGW, tid, lane); } SEAM(0); }
        if (RUN(1)) { REP(1) { pg8::Gemm g{(const bf16*)(ws + WS_XB), (const bf16*)(ws + WS_WIN), T, ZC, D / 2, D / 2, D / 2}; pg8::StaticOrder S; S.init(T, ZC, G, wg);
            pg8::EpiBf16<0> E{(bf16*)(ws + WS_Z), ZC, nullptr, 0, 0, 1.f / 64.f};
            auto S2 = MAKE_ORDER(1, S); pg8::gemm_phase<pg8::EpiBf16<0>, ORDER_T(1, pg8::StaticOrder), true, true, true>(lds, g, S2, E); } SEAM(1); }
        if (RUN(2)) { REP(2) { for (int it = wg; it < 1536; it += G) { if (it < 512) gdn_pre_item(p, l, lds, it, tid, wave, lane); else if (it < 1024) ml_pre_item(p, l, lds, it - 512, tid, wave, lane); else vt_item(p, lds, it - 1024, tid); } } SEAM(2); }
        if (RUN(3)) { REP(3) { phase_mixers(p, l, lds, wg, G, tid, wave, lane, bar); } SEAM(3); }
        if (RUN(4)) { REP(4) { phase_post(p, l, gw, NGW, lane); } SEAM(4); }
        if (RUN(5)) { REP(5) { pg8::Gemm g{(const bf16*)(ws + WS_BR), (const bf16*)(ws + WS_WBR), 4 * T, 4 * D, BW, BW, BW}; MergeOrder S{G, wg};
            EpiMerge E{(const bf16*)(ws + WS_Z), (float*)(ws + WS_MTMP), (bf16*)(ws + WS_MSUM)};
            auto S2 = MAKE_ORDER(5, S); pg8::gemm_phase<EpiMerge, ORDER_T(5, MergeOrder), true, true>(lds, g, S2, E); } SEAM(5); }
        if (RUN(6)) { REP(6) { pg8::Gemm g{(const bf16*)(ws + WS_MSUM), (const bf16*)(ws + WS_WOUT), T, D, D, D, D}; pg8::StaticOrder S; S.init(T, D, G, wg);
            EpiResid E{xin, (float*)(ws + WS_Y)};
            auto S2 = MAKE_ORDER(6, S); pg8::gemm_phase<EpiResid, ORDER_T(6, pg8::StaticOrder), true, true>(lds, g, S2, E); } SEAM(6); }
        if (RUN(7)) { REP(7) { phase_ln1_router(p, l, lds, wg, G, wave, lane, (PROBE_DUP == 7 && _r == 0) ? 16384 : 0); } SEAM(7); }
        if (RUN(8)) { REP(8) { const unsigned* cnt = (const unsigned*)(ws + WS_CTL) + CW_CNT + l * 4096; MoeTab M(lds); moe_tables(M, cnt, tid, lane, wave);
            UpOrder S{M, 0}; S.n = up_order_build(M, (const int*)(ws + WS_LIST), (const float*)(ws + WS_WL), wg, G, tid);
            pg8::Gemm g{(const bf16*)(ws + WS_X1B), (const bf16*)(ws + WS_WUP), T, NEX * 1024, D, D, D};
            EpiGluSparse E{(LAS const float*)M.wt, (bf16*)(ws + WS_HB)};
            auto S2 = MAKE_ORDER(8, S); pg8::gemm_phase_gather<EpiGluSparse, ORDER_T(8, UpOrder)>(lds, g, S2, E); } SEAM(8); }
        if (RUN(9)) { REP(9) { const unsigned* cnt = (const unsigned*)(ws + WS_CTL) + CW_CNT + l * 4096; MoeTab M(lds); moe_tables(M, cnt, tid, lane, wave);
            DownOrder S{M, G, wg, 8 * M.t[65]};
            pg8::Gemm g{(const bf16*)(ws + WS_HB), (const bf16*)(ws + WS_WDN), HROWS, NEX * D, ED, ED, ED};
            EpiYexp E{(bf16*)(ws + WS_YEXP)};
            auto S2 = MAKE_ORDER(9, S); pg8::gemm_phase<EpiYexp, ORDER_T(9, DownOrder), true, true>(lds, g, S2, E); } SEAM(9); }
        if (RUN(10)) { REP(10) { phase_combine_ln2(p, l, xout, gw, NGW, lane); } SEAM(10); }
#undef RUN
#undef SEAM
    }
}
__global__ void __launch_bounds__(512, 2) fwd_kernel(Params p) {
    extern __shared__ __attribute__((aligned(16))) unsigned char lds_raw[];
    LAS unsigned char* lds = (LAS unsigned char*)lds_raw;
    const int tid = threadIdx.x, lane = tid & 63, wave = __builtin_amdgcn_readfirstlane(tid >> 6);
    const int G = gridDim.x, wg = blockIdx.x, gw = wg * 8 + wave, NGW = G * 8;
    volatile LAS unsigned* MISC = (volatile LAS unsigned*)(lds + MISC_OFF);
    if (tid < 32) MISC[tid] = 0u;
    __syncthreads();
    unsigned* ctl = (unsigned*)(p.ws + WS_CTL);
    const bool multi = (p.ph_hi - p.ph_lo) > 1;
    XcdBarrier bar; bar.bar = ctl + CW_BAR; bar.x = 0; bar.st = nullptr;
    if (multi) bar = xcd_barrier_post(ctl + CW_BAR, MISC + 8);
    run_layer<0>(p, lds, bar, tid, lane, wave, G, wg, gw, NGW);
    run_layer<1>(p, lds, bar, tid, lane, wave, G, wg, gw, NGW);
}

#ifndef MK_MULTI_LAUNCH
#define MK_MULTI_LAUNCH 0
#endif
extern "C" void kernel_launch(void* const* d_in, const int* in_sizes, int n_in, void* d_out, int out_size, void* d_ws, size_t ws_size, hipStream_t stream) {
    static int grid = 0;
    if (grid == 0) {
        if (n_in != 27 || out_size != T * D || ws_size < WS_END) { fprintf(stderr, "kernel_launch: unexpected shapes (n_in %d out %d ws %zu need %zu)\n", n_in, out_size, ws_size, (size_t)WS_END); grid = -1; return; }
        int dev = 0, cus = 0, per_cu = 0;
        if (hipGetDevice(&dev) != hipSuccess || hipDeviceGetAttribute(&cus, hipDeviceAttributeMultiprocessorCount, dev) != hipSuccess) { grid = -1; return; }
        if (hipFuncSetAttribute((const void*)fwd_kernel, hipFuncAttributeMaxDynamicSharedMemorySize, LDS_BYTES) != hipSuccess) { fprintf(stderr, "kernel_launch: hipFuncSetAttribute failed\n"); grid = -1; return; }
        if (hipOccupancyMaxActiveBlocksPerMultiprocessor(&per_cu, (const void*)fwd_kernel, 512, LDS_BYTES) != hipSuccess || per_cu < 1) { fprintf(stderr, "kernel_launch: occupancy query says %d\n", per_cu); }
        (void)hipGetLastError();
        grid = cus;
    }
    if (grid < 0) return;
    (void)hipMemsetAsync((char*)d_ws + WS_CTL, 0, CTL_ZERO_BYTES, stream);
    Params p{};
    for (int i = 0; i < 27; ++i) p.in[i] = (const float*)d_in[i];
    p.out = (float*)d_out; p.ws = (unsigned char*)d_ws;
#if MK_MULTI_LAUNCH
    for (int ph = 0; ph < NL * NPH; ++ph) { p.ph_lo = ph; p.ph_hi = ph + 1; hipLaunchKernelGGL(fwd_kernel, dim3(grid), dim3(512), LDS_BYTES, stream, p); }
#else
    p.ph_lo = 0; p.ph_hi = NL * NPH; hipLaunchKernelGGL(fwd_kernel, dim3(grid), dim3(512), LDS_BYTES, stream, p);
#endif
}
```

```cpp
#include <hip/hip_runtime.h>
#include <cstdio>
#include <cstdint>
#include <type_traits>
namespace pg8 {
#define PG8_LAS __attribute__((address_space(3)))
typedef unsigned short bf16_t;
typedef short bf16x8 __attribute__((ext_vector_type(8)));
typedef float f32x4 __attribute__((ext_vector_type(4)));
typedef unsigned u32x4 __attribute__((ext_vector_type(4)));
constexpr int BM = 256, BK = 64, HALF = 128, HTB = HALF * BK * 2  , STAGE_BYTES = 8 * HTB, NXCD = 8, WGM = 8;

__host__ __device__ __forceinline__ int lds_byte(int r, int c) { const int st = (r >> 4) * 2 + (c >> 5), rr = r & 15, cc = c & 31, ob = rr * 64 + cc * 2; return st * 1024 + (ob ^ (((ob >> 9) & 1) << 5)); }
__host__ __device__ __forceinline__ void stage_rc(int b, int& R, int& C) { const int st = b / 1024, sb = b % 1024, swz = sb ^ (((sb >> 9) & 1) << 5); R = (st >> 1) * 16 + swz / 64; C = (st & 1) * 32 + (swz % 64) / 2; }
__host__ __device__ __forceinline__ int perm32(int rho) { const int n = rho >> 4, i = rho & 15; return 8 * (i >> 2) + 4 * n + (i & 3); }

struct Unit { int pm, pn, aux; };
struct Gemm { const bf16_t* A; const bf16_t* Bt; int M, N, K, lda, ldb; };

struct StaticOrder {
    int nM, nN, nwg, G, c;
    __host__ __device__ void init(int M, int N, int G_, int c_) { nM = M / BM; nN = N / BM; nwg = nM * nN; G = G_; c = c_; }
    __host__ __device__ bool next(int i, Unit& u) const {
        const long L = (long)i * G + c; if (L >= nwg) return false;
        int wgid = (int)L; { const int q = nwg / NXCD, r = nwg % NXCD, xcd = wgid % NXCD, off = wgid / NXCD; wgid = (xcd < r ? xcd * (q + 1) : r * (q + 1) + (xcd - r) * q) + off; }
        const int nig = WGM * nN, gid = wgid / nig, fm = gid * WGM, gsz = (nM - fm) < WGM ? (nM - fm) : WGM;
        u.pm = fm + ((wgid % nig) % gsz); u.pn = (wgid % nig) / gsz; return true;
    }
    __device__ __forceinline__ void a_ready(const Unit&) const {}
    __device__ __forceinline__ void done(const Unit&) const {}
};

__device__ __forceinline__ unsigned cvt_pk_bf16(float lo, float hi) { unsigned r; asm volatile("v_cvt_pk_bf16_f32 %0, %1, %2" : "=v"(r) : "v"(lo), "v"(hi)); return r; }
typedef float f32x2 __attribute__((ext_vector_type(2)));
__device__ __forceinline__ f32x2 gelu_pk(f32x2 v) {
    const f32x2 av = __builtin_elementwise_abs(v), d = av * 0.2316418882f + 1.0f;
    f32x2 t; t.x = __builtin_amdgcn_rcpf(d.x); t.y = __builtin_amdgcn_rcpf(d.y);
    f32x2 q = t * 0.5307027145f + (-0.7265760135f); q = q * t + 0.7107068705f; q = q * t + (-0.142248368f); q = q * t + 0.127414796f; q = q * t;
    const f32x2 s = (v * v) * (-0.72134752044f);
    f32x2 e; e.x = __builtin_amdgcn_exp2f(s.x); e.y = __builtin_amdgcn_exp2f(s.y);
    const f32x2 m = v * (q * e), r = v - m;
    f32x2 o; o.x = v.x < 0.f ? m.x : r.x; o.y = v.y < 0.f ? m.y : r.y; return o;
}

template <int ACT  > struct EpiBf16 {
    static constexpr bool PERM = true, AFTER_DRAIN = false; static_assert(ACT == 0 || ACT == 1, "EpiBf16: ACT is 0 (none) or 1 (gelu_pk)");
    bf16_t* O; int ldc; const float* bias; int split_cols; size_t split_stride; float scale0;
    __device__ __forceinline__ void operator()(const f32x4 (&acc)[2][2][4][2], const Unit& u, int wr, int wc, int fr, int fq) const {
        const int row0 = u.pm * BM + wr * 64 + fr; int colt = u.pn * BM; bf16_t* base = O;
        float sc = scale0; if (split_cols) { const int t = colt / split_cols; base += (size_t)t * split_stride; colt -= t * split_cols; if (t != 0) sc = 1.f; }
        const int col0 = colt + wc * 32 + 8 * fq, bcol0 = u.pn * BM + wc * 32 + 8 * fq;
        f32x4 bv[2][2];
#pragma unroll
        for (int bj = 0; bj < 2; ++bj)
#pragma unroll
            for (int n = 0; n < 2; ++n) bv[bj][n] = bias ? *(const f32x4*)(bias + bcol0 + bj * HALF + 4 * n) : (f32x4){0.f, 0.f, 0.f, 0.f};
#pragma unroll
        for (int ai = 0; ai < 2; ++ai)
#pragma unroll
            for (int m = 0; m < 4; ++m) { bf16_t* rowp = base + (size_t)(row0 + ai * HALF + m * 16) * ldc + col0;
#pragma unroll
                for (int bj = 0; bj < 2; ++bj) { f32x4 v0 = acc[ai][bj][m][0] + bv[bj][0], v1 = acc[ai][bj][m][1] + bv[bj][1];
                    if (ACT == 1) { f32x2 a = gelu_pk((f32x2){v0[0], v0[1]}), b = gelu_pk((f32x2){v0[2], v0[3]}), c = gelu_pk((f32x2){v1[0], v1[1]}), d = gelu_pk((f32x2){v1[2], v1[3]});
                        v0 = (f32x4){a.x, a.y, b.x, b.y}; v1 = (f32x4){c.x, c.y, d.x, d.y}; }
                    v0 = v0 * sc; v1 = v1 * sc; u32x4 w; w.x = cvt_pk_bf16(v0[0], v0[1]); w.y = cvt_pk_bf16(v0[2], v0[3]); w.z = cvt_pk_bf16(v1[0], v1[1]); w.w = cvt_pk_bf16(v1[2], v1[3]);
                    *(u32x4*)(rowp + bj * HALF) = w; } }
    }
};

typedef int i32x8 __attribute__((ext_vector_type(8)));
__device__ __forceinline__ i32x8 cat8(const bf16x8 a, const bf16x8 b) { typedef int i32x4 __attribute__((ext_vector_type(4))); const i32x4 x = __builtin_bit_cast(i32x4, a), y = __builtin_bit_cast(i32x4, b); return (i32x8){x[0], x[1], x[2], x[3], y[0], y[1], y[2], y[3]}; }
__device__ __forceinline__ bf16x8 lo8(const i32x8 v) { typedef int i32x4 __attribute__((ext_vector_type(4))); return __builtin_bit_cast(bf16x8, __builtin_shufflevector(v, v, 0, 1, 2, 3)); }
__device__ __forceinline__ bf16x8 hi8(const i32x8 v) { typedef int i32x4 __attribute__((ext_vector_type(4))); return __builtin_bit_cast(bf16x8, __builtin_shufflevector(v, v, 4, 5, 6, 7)); }
template <class Epi, class Sched, bool ALIGN_EPI = false, bool SP2 = false, bool FP8 = false>
__device__ __forceinline__ void gemm_phase(PG8_LAS unsigned char* lds, const Gemm g, const Sched& S, const Epi& E) {
    const int tid = threadIdx.x, wid = __builtin_amdgcn_readfirstlane(tid >> 6), lane = tid & 63, wr = wid >> 2, wc = wid & 3, fr = lane & 15, fq = lane >> 4;
    const int K = g.K, nt = K / BK;
    unsigned voffA[2], voffB[2];
#pragma unroll
    for (int i = 0; i < 2; ++i) { int R, C; stage_rc(tid * 16 + i * 8192, R, C); const int Rb = Epi::PERM ? ((R & ~31) + perm32(R & 31)) : R;
        voffA[i] = (unsigned)(R * g.lda + C) * 2u; voffB[i] = (unsigned)(Rb * g.ldb + C) * 2u; }
    const size_t kstep = (size_t)(BK * 2);
    const size_t hstepA = (size_t)HALF * g.lda * 2, hstepB = (size_t)HALF * g.ldb * 2;
    const size_t tstepA = 2 * hstepA, tstepB = 2 * hstepB;
    const unsigned ldsw = (unsigned)wid * 1024u;
    const int aoff = lds_byte(wr * 64 + fr, fq * 8), boff = lds_byte(wc * 32 + fr, fq * 8);
#define PG8_SA(b, h) (((b) * 2 + (h)) * HTB)
#define PG8_SB(b, h) ((4 + (b) * 2 + (h)) * HTB)
#define PG8_STAGE(bufoff, gbase, voff) do { _Pragma("unroll") for (int _i = 0; _i < 2; ++_i) \
        __builtin_amdgcn_global_load_lds((const unsigned*)((const char*)(gbase) + (voff)[_i]), (PG8_LAS unsigned*)(lds + (bufoff) + ldsw + _i * 8192), 16, 0, 0); } while (0)
#define PG8_LDA(dst, b, h) do { _Pragma("unroll") for (int m = 0; m < 4; ++m) { if constexpr (FP8) dst##8[m] = cat8(*(const PG8_LAS bf16x8*)(lds + PG8_SA(b, h) + aoff + m * 2048), *(const PG8_LAS bf16x8*)(lds + PG8_SA(b, h) + aoff + m * 2048 + 1024)); \
        else { _Pragma("unroll") for (int k = 0; k < 2; ++k) dst[m][k] = *(const PG8_LAS bf16x8*)(lds + PG8_SA(b, h) + aoff + m * 2048 + k * 1024); } } } while (0)
#define PG8_LDB(dst, b, h) do { _Pragma("unroll") for (int n = 0; n < 2; ++n) { if constexpr (FP8) dst##8[n] = cat8(*(const PG8_LAS bf16x8*)(lds + PG8_SB(b, h) + boff + n * 2048), *(const PG8_LAS bf16x8*)(lds + PG8_SB(b, h) + boff + n * 2048 + 1024)); \
        else { _Pragma("unroll") for (int k = 0; k < 2; ++k) dst[n][k] = *(const PG8_LAS bf16x8*)(lds + PG8_SB(b, h) + boff + n * 2048 + k * 1024); } } } while (0)
#define PG8_MMA(ai, bj, At, Bt) do { __builtin_amdgcn_s_setprio(1); _Pragma("unroll") for (int m = 0; m < 4; ++m) _Pragma("unroll") for (int n = 0; n < 2; ++n) { \
        if constexpr (FP8) asm volatile("v_mfma_scale_f32_16x16x128_f8f6f4 %0, %1, %2, %0, %3, %3 op_sel_hi:[0,0,0]" : "+v"(acc[ai][bj][m][n]) : "v"(Bt##8[n]), "v"(At##8[m]), "v"(fp8_unit_scale)); \
        else { _Pragma("unroll") for (int k = 0; k < 2; ++k) acc[ai][bj][m][n] = __builtin_amdgcn_mfma_f32_16x16x32_bf16(Bt[n][k], At[m][k], acc[ai][bj][m][n], 0, 0, 0); } } __builtin_amdgcn_s_setprio(0); } while (0)
#define PG8_WAIT_V(n) asm volatile("s_waitcnt vmcnt(" #n ")" ::: "memory")
#define PG8_WAIT_L(n) asm volatile("s_waitcnt lgkmcnt(" #n ")" ::: "memory")
#define PG8_BAR __builtin_amdgcn_s_barrier()
#define PG8_SCHED __builtin_amdgcn_sched_barrier(0)
    Unit cur, nxt; int ui = 0;
    if (!S.next(0, cur)) return;
    f32x4 acc[2][2][4][2];
#pragma unroll
    for (int a = 0; a < 2; ++a)
#pragma unroll
        for (int b = 0; b < 2; ++b)
#pragma unroll
            for (int m = 0; m < 4; ++m)
#pragma unroll
                for (int n = 0; n < 2; ++n) acc[a][b][m][n] = (f32x4){0.f, 0.f, 0.f, 0.f};
    int fp8_unit_scale = 0x7F7F7F7F; asm volatile("" : "+v"(fp8_unit_scale));
    bf16x8 At[4][2], B0[2][2], B1[2][2];
    i32x8 At8[4], B08[2], B18[2];
    const char* cA = (const char*)g.A + (size_t)cur.pm * tstepA; const char* cB = (const char*)g.Bt + (size_t)cur.pn * tstepB;
    S.a_ready(cur);
    if constexpr (SP2) {
        PG8_STAGE(PG8_SB(0, 0), cB, voffB); PG8_STAGE(PG8_SB(0, 1), cB + hstepB, voffB); PG8_STAGE(PG8_SA(0, 0), cA, voffA); PG8_STAGE(PG8_SA(0, 1), cA + hstepA, voffA);
        if (wr == 1) PG8_BAR;
        PG8_WAIT_V(2); PG8_BAR;
        PG8_STAGE(PG8_SB(1, 0), cB + kstep, voffB); PG8_STAGE(PG8_SA(1, 0), cA + kstep, voffA); PG8_STAGE(PG8_SB(1, 1), cB + hstepB + kstep, voffB);
        PG8_WAIT_V(6); PG8_BAR;
    } else {
        PG8_STAGE(PG8_SB(0, 0), cB, voffB); PG8_STAGE(PG8_SA(0, 0), cA, voffA); PG8_STAGE(PG8_SB(0, 1), cB + hstepB, voffB); PG8_STAGE(PG8_SA(0, 1), cA + hstepA, voffA);
        if (wr == 1) PG8_BAR;
        PG8_WAIT_V(4); PG8_BAR;
        PG8_STAGE(PG8_SB(1, 0), cB + kstep, voffB); PG8_STAGE(PG8_SA(1, 0), cA + kstep, voffA); PG8_STAGE(PG8_SB(1, 1), cB + hstepB + kstep, voffB);
        PG8_WAIT_V(6); PG8_BAR;
    }
    for (;;) {
        const bool has_next = S.next(ui + 1, nxt);
        const char* nA = has_next ? (const char*)g.A + (size_t)nxt.pm * tstepA : cA; const char* nB = has_next ? (const char*)g.Bt + (size_t)nxt.pn * tstepB : cB;
        for (int t = 0; t < nt; t += 2) {
            const bool last = (t == nt - 2);
            const char* a1 = cA + (size_t)(t + 1) * kstep;
            const char* a2 = last ? nA : cA + (size_t)(t + 2) * kstep; const char* b2 = last ? nB : cB + (size_t)(t + 2) * kstep;
            const char* a3 = a2 + kstep; const char* b3 = b2 + kstep;
            if (last && has_next) S.a_ready(nxt);
            if constexpr (SP2) {
            PG8_LDB(B0, 0, 0); PG8_LDB(B1, 0, 1); PG8_SCHED; PG8_LDA(At, 0, 0); PG8_STAGE(PG8_SA(1, 1), a1 + hstepA, voffA);
            PG8_WAIT_V(8); PG8_WAIT_L(0); PG8_BAR; PG8_MMA(0, 0, At, B0); PG8_MMA(0, 1, At, B1); PG8_BAR; PG8_SCHED;
            PG8_LDA(At, 0, 1); PG8_STAGE(PG8_SB(0, 0), b2, voffB); PG8_STAGE(PG8_SB(0, 1), b2 + hstepB, voffB); PG8_STAGE(PG8_SA(0, 0), a2, voffA);
            PG8_WAIT_V(8); PG8_WAIT_L(0); PG8_BAR; PG8_MMA(1, 0, At, B0); PG8_MMA(1, 1, At, B1); PG8_BAR; PG8_SCHED;
            PG8_LDB(B0, 1, 0); PG8_LDB(B1, 1, 1); PG8_SCHED; PG8_LDA(At, 1, 0); PG8_STAGE(PG8_SA(0, 1), a2 + hstepA, voffA);
            PG8_WAIT_V(8); PG8_WAIT_L(0); PG8_BAR; PG8_MMA(0, 0, At, B0); PG8_MMA(0, 1, At, B1); PG8_BAR; PG8_SCHED;
            PG8_LDA(At, 1, 1); PG8_STAGE(PG8_SB(1, 0), b3, voffB); PG8_STAGE(PG8_SB(1, 1), b3 + hstepB, voffB); PG8_STAGE(PG8_SA(1, 0), a3, voffA);
            PG8_WAIT_V(8); PG8_WAIT_L(0); PG8_BAR; PG8_MMA(1, 0, At, B0); PG8_MMA(1, 1, At, B1); PG8_BAR; PG8_SCHED;
            } else {
            PG8_LDB(B0, 0, 0); PG8_SCHED; PG8_LDA(At, 0, 0); PG8_STAGE(PG8_SA(1, 1), a1 + hstepA, voffA);
            PG8_WAIT_L(8); PG8_BAR; PG8_WAIT_L(0); PG8_MMA(0, 0, At, B0); PG8_BAR; PG8_SCHED;
            PG8_LDB(B1, 0, 1); PG8_STAGE(PG8_SB(0, 0), b2, voffB);
            PG8_BAR; PG8_WAIT_L(0); PG8_MMA(0, 1, At, B1); PG8_BAR;
            PG8_LDA(At, 0, 1); PG8_STAGE(PG8_SA(0, 0), a2, voffA);
            PG8_BAR; PG8_WAIT_L(0); PG8_MMA(1, 0, At, B0); PG8_BAR; PG8_SCHED;
            PG8_STAGE(PG8_SB(0, 1), b2 + hstepB, voffB);
            PG8_WAIT_V(6); PG8_BAR; PG8_MMA(1, 1, At, B1); PG8_BAR;
            PG8_LDB(B0, 1, 0); PG8_SCHED; PG8_LDA(At, 1, 0); PG8_STAGE(PG8_SA(0, 1), a2 + hstepA, voffA);
            PG8_WAIT_L(8); PG8_BAR; PG8_WAIT_L(0); PG8_MMA(0, 0, At, B0); PG8_BAR; PG8_SCHED;
            PG8_LDB(B1, 1, 1); PG8_STAGE(PG8_SB(1, 0), b3, voffB);
            PG8_BAR; PG8_WAIT_L(0); PG8_MMA(0, 1, At, B1); PG8_BAR;
            PG8_LDA(At, 1, 1); PG8_STAGE(PG8_SA(1, 0), a3, voffA);
            PG8_BAR; PG8_WAIT_L(0); PG8_MMA(1, 0, At, B0); PG8_BAR; PG8_SCHED;
            PG8_STAGE(PG8_SB(1, 1), b3 + hstepB, voffB);
            PG8_WAIT_V(6); PG8_BAR; PG8_MMA(1, 1, At, B1); PG8_BAR;
            }
        }
        if constexpr (ALIGN_EPI) { if (wr == 0) PG8_BAR; }
        if constexpr (FP8) asm volatile("s_nop 7\n\ts_nop 7" ::: "memory");
        if constexpr (!Epi::AFTER_DRAIN) { E(acc, cur, wr, wc, fr, fq); S.done(cur); }
        if (!has_next) break;
#pragma unroll
        for (int a = 0; a < 2; ++a)
#pragma unroll
            for (int b = 0; b < 2; ++b)
#pragma unroll
                for (int m = 0; m < 4; ++m)
#pragma unroll
                    for (int n = 0; n < 2; ++n) acc[a][b][m][n] = (f32x4){0.f, 0.f, 0.f, 0.f};
        cur = nxt; cA = nA; cB = nB; ++ui;
        if constexpr (ALIGN_EPI) { if (wr == 1) PG8_BAR; }
    }
    PG8_WAIT_V(0);
    if constexpr (!ALIGN_EPI) { if (wr == 0) PG8_BAR; }
    PG8_BAR;
    if constexpr (Epi::AFTER_DRAIN) { E.fused(acc, cur, wr, wc, fr, fq, lds, wid, lane); S.done(cur); }
#undef PG8_SA
#undef PG8_SB
#undef PG8_STAGE
#undef PG8_LDA
#undef PG8_LDB
#undef PG8_MMA
#undef PG8_WAIT_V
#undef PG8_WAIT_L
#undef PG8_BAR
#undef PG8_SCHED
}
template <class Epi, class Sched, bool FP8 = false>
__device__ __forceinline__ void gemm_phase_gather(PG8_LAS unsigned char* lds, const Gemm g, const Sched& S, const Epi& E) {
    const int tid = threadIdx.x, wid = __builtin_amdgcn_readfirstlane(tid >> 6), lane = tid & 63, wr = wid >> 2, wc = wid & 3, fr = lane & 15, fq = lane >> 4;
    const int K = g.K, nt = K / BK;
    unsigned voffB[2]; int RA[2], CA[2];
#pragma unroll
    for (int i = 0; i < 2; ++i) { int R, C; stage_rc(tid * 16 + i * 8192, R, C); const int Rb = Epi::PERM ? ((R & ~31) + perm32(R & 31)) : R;
        RA[i] = R; CA[i] = C; voffB[i] = (unsigned)(Rb * g.ldb + C) * 2u; }
    const size_t kstep = (size_t)(BK * 2);
    const size_t hstepB = (size_t)HALF * g.ldb * 2, tstepB = 2 * hstepB;
    const unsigned ldsw = (unsigned)wid * 1024u;
    const int aoff = lds_byte(wr * 64 + fr, fq * 8), boff = lds_byte(wc * 32 + fr, fq * 8);
#define PG8_SA(b, h) (((b) * 2 + (h)) * HTB)
#define PG8_SB(b, h) ((4 + (b) * 2 + (h)) * HTB)
#define PG8_STAGE(bufoff, gbase, voff) do { _Pragma("unroll") for (int _i = 0; _i < 2; ++_i) \
        __builtin_amdgcn_global_load_lds((const unsigned*)((const char*)(gbase) + (voff)[_i]), (PG8_LAS unsigned*)(lds + (bufoff) + ldsw + _i * 8192), 16, 0, 0); } while (0)
#define PG8_LDA(dst, b, h) do { _Pragma("unroll") for (int m = 0; m < 4; ++m) { if constexpr (FP8) dst##8[m] = cat8(*(const PG8_LAS bf16x8*)(lds + PG8_SA(b, h) + aoff + m * 2048), *(const PG8_LAS bf16x8*)(lds + PG8_SA(b, h) + aoff + m * 2048 + 1024)); \
        else { _Pragma("unroll") for (int k = 0; k < 2; ++k) dst[m][k] = *(const PG8_LAS bf16x8*)(lds + PG8_SA(b, h) + aoff + m * 2048 + k * 1024); } } } while (0)
#define PG8_LDB(dst, b, h) do { _Pragma("unroll") for (int n = 0; n < 2; ++n) { if constexpr (FP8) dst##8[n] = cat8(*(const PG8_LAS bf16x8*)(lds + PG8_SB(b, h) + boff + n * 2048), *(const PG8_LAS bf16x8*)(lds + PG8_SB(b, h) + boff + n * 2048 + 1024)); \
        else { _Pragma("unroll") for (int k = 0; k < 2; ++k) dst[n][k] = *(const PG8_LAS bf16x8*)(lds + PG8_SB(b, h) + boff + n * 2048 + k * 1024); } } } while (0)
#define PG8_MMA(ai, bj, At, Bt) do { __builtin_amdgcn_s_setprio(1); _Pragma("unroll") for (int m = 0; m < 4; ++m) _Pragma("unroll") for (int n = 0; n < 2; ++n) { \
        if constexpr (FP8) asm volatile("v_mfma_scale_f32_16x16x128_f8f6f4 %0, %1, %2, %0, %3, %3 op_sel_hi:[0,0,0]" : "+v"(acc[ai][bj][m][n]) : "v"(Bt##8[n]), "v"(At##8[m]), "v"(fp8_unit_scale)); \
        else { _Pragma("unroll") for (int k = 0; k < 2; ++k) acc[ai][bj][m][n] = __builtin_amdgcn_mfma_f32_16x16x32_bf16(Bt[n][k], At[m][k], acc[ai][bj][m][n], 0, 0, 0); } } __builtin_amdgcn_s_setprio(0); } while (0)
#define PG8_WAIT_V(n) asm volatile("s_waitcnt vmcnt(" #n ")" ::: "memory")
#define PG8_WAIT_L(n) asm volatile("s_waitcnt lgkmcnt(" #n ")" ::: "memory")
#define PG8_BAR __builtin_amdgcn_s_barrier()
#define PG8_SCHED __builtin_amdgcn_sched_barrier(0)
#define PG8_ROWS(dst, ui_) do { _Pragma("unroll") for (int _h = 0; _h < 2; ++_h) _Pragma("unroll") for (int _i = 0; _i < 2; ++_i) \
        dst[_h][_i] = (unsigned)S.row_token((ui_), _h * HALF + RA[_i]) * (unsigned)(g.lda * 2) + (unsigned)(CA[_i] * 2); } while (0)
    Unit cur, nxt; int ui = 0;
    if (!S.next(0, cur)) return;
    f32x4 acc[2][2][4][2];
#pragma unroll
    for (int a = 0; a < 2; ++a)
#pragma unroll
        for (int b = 0; b < 2; ++b)
#pragma unroll
            for (int m = 0; m < 4; ++m)
#pragma unroll
                for (int n = 0; n < 2; ++n) acc[a][b][m][n] = (f32x4){0.f, 0.f, 0.f, 0.f};
    int fp8_unit_scale = 0x7F7F7F7F; asm volatile("" : "+v"(fp8_unit_scale));
    bf16x8 At[4][2], B0[2][2], B1[2][2];
    i32x8 At8[4], B08[2], B18[2];
    unsigned offC[2][2];
    PG8_ROWS(offC, 0);
    const char* gA = (const char*)g.A;
    const char* cB = (const char*)g.Bt + (size_t)cur.pn * tstepB;
    PG8_STAGE(PG8_SB(0, 0), cB, voffB); PG8_STAGE(PG8_SB(0, 1), cB + hstepB, voffB); PG8_STAGE(PG8_SA(0, 0), gA, offC[0]); PG8_STAGE(PG8_SA(0, 1), gA, offC[1]);
    if (wr == 1) PG8_BAR;
    PG8_WAIT_V(2); PG8_BAR;
    PG8_STAGE(PG8_SB(1, 0), cB + kstep, voffB); PG8_STAGE(PG8_SA(1, 0), gA + kstep, offC[0]); PG8_STAGE(PG8_SB(1, 1), cB + hstepB + kstep, voffB);
    PG8_WAIT_V(6); PG8_BAR;
    for (;;) {
        const bool has_next = S.next(ui + 1, nxt);
        const char* nB = has_next ? (const char*)g.Bt + (size_t)nxt.pn * tstepB : cB;
        for (int t = 0; t < nt; t += 2) {
            const bool last = (t == nt - 2);
            const char* a1 = gA + (size_t)(t + 1) * kstep;
            const char* a2 = last ? gA : gA + (size_t)(t + 2) * kstep; const char* b2 = last ? nB : cB + (size_t)(t + 2) * kstep;
            const char* a3 = a2 + kstep; const char* b3 = b2 + kstep;
            PG8_LDB(B0, 0, 0); PG8_LDB(B1, 0, 1); PG8_SCHED; PG8_LDA(At, 0, 0); PG8_STAGE(PG8_SA(1, 1), a1, offC[1]);
            if (last && has_next) { PG8_ROWS(offC, ui + 1); }
            PG8_WAIT_V(8); PG8_WAIT_L(0); PG8_BAR; PG8_MMA(0, 0, At, B0); PG8_MMA(0, 1, At, B1); PG8_BAR; PG8_SCHED;
            PG8_LDA(At, 0, 1); PG8_STAGE(PG8_SB(0, 0), b2, voffB); PG8_STAGE(PG8_SB(0, 1), b2 + hstepB, voffB); PG8_STAGE(PG8_SA(0, 0), a2, offC[0]);
            PG8_WAIT_V(8); PG8_WAIT_L(0); PG8_BAR; PG8_MMA(1, 0, At, B0); PG8_MMA(1, 1, At, B1); PG8_BAR; PG8_SCHED;
            PG8_LDB(B0, 1, 0); PG8_LDB(B1, 1, 1); PG8_SCHED; PG8_LDA(At, 1, 0); PG8_STAGE(PG8_SA(0, 1), a2, offC[1]);
            PG8_WAIT_V(8); PG8_WAIT_L(0); PG8_BAR; PG8_MMA(0, 0, At, B0); PG8_MMA(0, 1, At, B1); PG8_BAR; PG8_SCHED;
            PG8_LDA(At, 1, 1); PG8_STAGE(PG8_SB(1, 0), b3, voffB); PG8_STAGE(PG8_SB(1, 1), b3 + hstepB, voffB); PG8_STAGE(PG8_SA(1, 0), a3, offC[0]);
            PG8_WAIT_V(8); PG8_WAIT_L(0); PG8_BAR; PG8_MMA(1, 0, At, B0); PG8_MMA(1, 1, At, B1); PG8_BAR; PG8_SCHED;
        }
        if (wr == 0) PG8_BAR;
        if constexpr (FP8) asm volatile("s_nop 7\n\ts_nop 7" ::: "memory");
        E(acc, cur, wr, wc, fr, fq); S.done(cur);
        if (!has_next) break;
#pragma unroll
        for (int a = 0; a < 2; ++a)
#pragma unroll
            for (int b = 0; b < 2; ++b)
#pragma unroll
                for (int m = 0; m < 4; ++m)
#pragma unroll
                    for (int n = 0; n < 2; ++n) acc[a][b][m][n] = (f32x4){0.f, 0.f, 0.f, 0.f};
        cur = nxt; cB = nB; ++ui;
        if (wr == 1) PG8_BAR;
    }
    PG8_WAIT_V(0);
    PG8_BAR;
#undef PG8_ROWS
#undef PG8_SA
#undef PG8_SB
#undef PG8_STAGE
#undef PG8_LDA
#undef PG8_LDB
#undef PG8_MMA
#undef PG8_WAIT_V
#undef PG8_WAIT_L
#undef PG8_BAR
#undef PG8_SCHED
}
}

#ifndef MOE_UP_FP8
#define MOE_UP_FP8 1
#endif
#ifndef PROBE_NOATOM
#define PROBE_NOATOM 0
#endif
constexpr int T = 8192, D = 2048, NL = 2, BW = 512, ZC = 14336, INC = 14352;
constexpr int NE = 64, NEX = 65  , ED = 512;
constexpr int HK = NEX * ED;
constexpr float ALPHA = 1.41421356237f;
constexpr float LN_EPS = 1e-5f;
constexpr float UPSC = MOE_UP_FP8 ? (1.f / 64.f) : 1.f;
constexpr int ZC_SBQ = 0, ZC_SBK = 512, ZC_SBV = 1024, ZC_GMU = 1536, ZC_GMV = 2048, ZC_GDN = 2560, ZC_GDNG = 4096,
              ZC_MLQ = 4608, ZC_MLK = 4864, ZC_MLV = 5120, ZC_MLO = 5632, ZC_GATE = 6144;

#define GAS __attribute__((address_space(1)))
#define LAS __attribute__((address_space(3)))
typedef unsigned short bf16;
typedef unsigned v4u __attribute__((ext_vector_type(4)));
typedef unsigned v2u __attribute__((ext_vector_type(2)));
typedef float v4f __attribute__((ext_vector_type(4)));
typedef float v2f __attribute__((ext_vector_type(2)));
#define LDS_WAIT() asm volatile("s_waitcnt lgkmcnt(0)" ::: "memory")
#define LDS_BAR() do { asm volatile("s_waitcnt lgkmcnt(0)" ::: "memory"); __builtin_amdgcn_s_barrier(); asm volatile("" ::: "memory"); } while (0)

constexpr size_t MiB = 1u << 20;
constexpr size_t WS_CTL = 0, CTL_ZERO_BYTES = 1 * MiB;
constexpr size_t WS_WIN = 2 * MiB, WS_WBR = 58 * MiB, WS_WOUT = 66 * MiB, WS_WUP = 74 * MiB, WS_WDN = 334 * MiB;
constexpr size_t WS_XB = 464 * MiB, WS_SMALL = 496 * MiB, WS_EG = 497 * MiB, WS_BETA = WS_EG + 256 * 1024, WS_COMB = 498 * MiB;
constexpr size_t WS_Z = 500 * MiB, WS_GQ = 724 * MiB, WS_GK = 740 * MiB, WS_GV = 756 * MiB, WS_GO = 772 * MiB, WS_HO = 788 * MiB;
constexpr size_t WS_BR = 804 * MiB, WS_MTMP = 836 * MiB, WS_MSUM = 900 * MiB, WS_Y = 932 * MiB, WS_X1 = 996 * MiB, WS_X1B = 1060 * MiB;
constexpr size_t WS_XCUR = 1092 * MiB, WS_HB = 1156 * MiB, WS_YEXP = 1236 * MiB, WS_LIST = 1524 * MiB, WS_WL = 1526 * MiB, WS_SLOT = 1528 * MiB, WS_MQ = 1530 * MiB, WS_MS = 1534 * MiB, WS_MK = 1538 * MiB, WS_MV = 1542 * MiB, WS_MFL = 1552 * MiB, WS_HDEN = WS_MFL + 65536, WS_VT = 1553 * MiB, WS_END = 1561 * MiB;
constexpr size_t WS_GU = WS_GQ, WS_GNW = WS_GK, WS_GQG = WS_GK + 8 * MiB, WS_GKT = WS_GV, WS_GAT = WS_GV + 8 * MiB, WS_GDL = WS_GV + 12 * MiB;
constexpr int HROWS = 73728;
static_assert(WS_HB + (size_t)HROWS * ED * 2 <= WS_YEXP && WS_YEXP + (size_t)HROWS * D * 2 <= WS_LIST, "ws map (moe)");
static_assert(WS_WIN + (size_t)ZC * D * 2 <= WS_WBR && WS_WUP + (size_t)NEX * 1024 * D * 2 <= WS_WDN && WS_WDN + (size_t)D * HK * 2 <= WS_XB, "ws map (weights)");
static_assert(WS_Z + (size_t)T * ZC * 2 <= WS_GQ, "ws map (acts)");
constexpr int CW_BAR = 4096, CW_CNT = 16384;
constexpr int TAB_OFF = 131072 + 1024;
constexpr int LDS_BYTES = 163840, MISC_OFF = 131072 + 320;

__device__ __forceinline__ float bflo(unsigned w) { return __uint_as_float(w << 16); }
__device__ __forceinline__ float bfhi(unsigned w) { return __uint_as_float(w & 0xffff0000u); }
__device__ __forceinline__ unsigned f2bf(float f) { unsigned u = __float_as_uint(f); return (u + 0x7fffu + ((u >> 16) & 1u)) >> 16; }
__device__ __forceinline__ unsigned pk2(float lo, float hi) { return f2bf(lo) | (f2bf(hi) << 16); }
template <int CTRL> __device__ __forceinline__ float dpp(float x) { return __builtin_bit_cast(float, __builtin_amdgcn_mov_dpp(__builtin_bit_cast(int, x), CTRL, 0xf, 0xf, true)); }
__device__ __forceinline__ float sum4(float x) { x += dpp<0xB1>(x); x += dpp<0x4E>(x); return x; }
__device__ __forceinline__ float sum8(float x) { x = sum4(x); x += dpp<0x141>(x); return x; }
__device__ __forceinline__ float sum16(float x) { x = sum8(x); x += dpp<0x140>(x); return x; }
__device__ __forceinline__ float wave_sum(float x) { x = sum16(x); x += __shfl_xor(x, 16); x += __shfl_xor(x, 32); return x; }
__device__ __forceinline__ float max8(float x) { x = fmaxf(x, dpp<0xB1>(x)); x = fmaxf(x, dpp<0x4E>(x)); x = fmaxf(x, dpp<0x141>(x)); return x; }
__device__ __forceinline__ float min8(float x) { x = fminf(x, dpp<0xB1>(x)); x = fminf(x, dpp<0x4E>(x)); x = fminf(x, dpp<0x141>(x)); return x; }
__device__ __forceinline__ float wave_scan_incl(float v) {
    v += __builtin_bit_cast(float, __builtin_amdgcn_update_dpp(0, __builtin_bit_cast(int, v), 0x111, 0xf, 0xf, true));
    v += __builtin_bit_cast(float, __builtin_amdgcn_update_dpp(0, __builtin_bit_cast(int, v), 0x112, 0xf, 0xf, true));
    v += __builtin_bit_cast(float, __builtin_amdgcn_update_dpp(0, __builtin_bit_cast(int, v), 0x114, 0xf, 0xf, true));
    v += __builtin_bit_cast(float, __builtin_amdgcn_update_dpp(0, __builtin_bit_cast(int, v), 0x118, 0xf, 0xf, true));
    v += __builtin_bit_cast(float, __builtin_amdgcn_update_dpp(0, __builtin_bit_cast(int, v), 0x142, 0xa, 0xf, false));
    v += __builtin_bit_cast(float, __builtin_amdgcn_update_dpp(0, __builtin_bit_cast(int, v), 0x143, 0xc, 0xf, false));
    return v;
}
__device__ __forceinline__ float sigmoidf_(float x) { return 1.f / (1.f + __expf(-x)); }
__device__ __forceinline__ float siluf_(float x) { return x / (1.f + __expf(-x)); }
__device__ __forceinline__ float softplusf_(float x) { return fmaxf(x, 0.f) + __logf(1.f + __expf(-fabsf(x))); }
__device__ __forceinline__ float gelu_tanh(float x) { const float y = 0.7978845608f * (x + 0.044715f * x * x * x); const float t = 1.f - 2.f / (__expf(2.f * y) + 1.f); return 0.5f * x * (1.f + t); }
__device__ __forceinline__ void unpack8(const v4u r, float (&f)[8]) { f[0] = bflo(r.x); f[1] = bfhi(r.x); f[2] = bflo(r.y); f[3] = bfhi(r.y); f[4] = bflo(r.z); f[5] = bfhi(r.z); f[6] = bflo(r.w); f[7] = bfhi(r.w); }
#define XB_TMO      128
#define XB_XCNT(j)  (256  + 64 * (j))
#define XB_XSUB(j)  (1280 + 64 * (j))
#define XB_XGEN(j)  (2304 + 64 * (j))
#define XB_TOP      3328
#define XB_TOPGEN   3392
#define XCD_BAR_WORDS 3456
#define XB_SPIN_CAP (1u << 18)

__device__ __forceinline__ unsigned xb_ld(unsigned* p)              { return __hip_atomic_load(p, __ATOMIC_RELAXED, __HIP_MEMORY_SCOPE_AGENT); }
__device__ __forceinline__ unsigned xb_add(unsigned* p, unsigned v) { return __hip_atomic_fetch_add(p, v, __ATOMIC_RELAXED, __HIP_MEMORY_SCOPE_AGENT); }
__device__ __forceinline__ unsigned xb_xcc_id() { return (unsigned)__builtin_amdgcn_s_getreg((3 << 11) | 20) & 0xFu; }
#define XB_SPIN(cond, bar) do { unsigned _sp = 0; while (cond) { __builtin_amdgcn_s_sleep(1); \
    if ((++_sp & 255u) == 0u) { if (xb_ld(&(bar)[XB_TMO])) break; if (_sp > XB_SPIN_CAP) { atomicAdd(&(bar)[XB_TMO], 1u); break; } } } } while (0)

struct XcdBarrier {
    unsigned* bar; unsigned x;
    volatile LAS unsigned* st;
};

__device__ __forceinline__ XcdBarrier xcd_barrier_post(unsigned* bar, volatile LAS unsigned* st) {
    XcdBarrier b; b.bar = bar; b.x = xb_xcc_id(); b.st = st;
    if (threadIdx.x == 0) (void)xb_add(&bar[XB_XCNT(b.x)], 1u);
    return b;
}
__device__ __forceinline__ void xcd_barrier_complete(unsigned* bar, unsigned x, unsigned& nloc, unsigned& nx) {
    const unsigned G = gridDim.x * gridDim.y * gridDim.z;
    unsigned sum, cnt, mine, sp = 0u;
    for (;;) {
        sum = 0u; cnt = 0u; mine = 0u;
#pragma unroll
        for (unsigned j = 0; j < 16; ++j) { const unsigned c = xb_ld(&bar[XB_XCNT(j)]); sum += c; cnt += (c > 0u) ? 1u : 0u; mine = (j == x) ? c : mine; }
        if (sum == G) break;
        __builtin_amdgcn_s_sleep(1);
        if ((++sp & 255u) == 0u) { if (xb_ld(&bar[XB_TMO])) break; if (sp > XB_SPIN_CAP) { atomicAdd(&bar[XB_TMO], 1u); break; } }
    }
    nloc = mine > 0u ? mine : 1u; nx = cnt > 0u ? cnt : 1u;
}

__device__ __forceinline__ void xcd_barrier(const XcdBarrier& b) {
    asm volatile("s_waitcnt vmcnt(0)" ::: "memory");
    __syncthreads();
    if (threadIdx.x == 0) {
        unsigned* bar = b.bar;
        __builtin_amdgcn_s_waitcnt(0);
        unsigned nloc = b.st[0], nx = b.st[1];
        if (nloc == 0u) { xcd_barrier_complete(bar, b.x, nloc, nx); b.st[0] = nloc; b.st[1] = nx; }
        const unsigned old = xb_add(&bar[XB_XSUB(b.x)], 1u);
        const unsigned gen = old / nloc;
        if (old + 1u == (gen + 1u) * nloc) {
            __builtin_amdgcn_fence(__ATOMIC_RELEASE, "agent");
            asm volatile("s_waitcnt vmcnt(0)" ::: "memory");
            const unsigned og = xb_add(&bar[XB_TOP], 1u);
            const unsigned tg = og / nx;
            if (og + 1u == (tg + 1u) * nx) xb_add(&bar[XB_TOPGEN], 1u);
            else XB_SPIN(xb_ld(&bar[XB_TOPGEN]) == tg, bar);
            __builtin_amdgcn_fence(__ATOMIC_ACQUIRE, "agent");
            xb_add(&bar[XB_XGEN(b.x)], 1u);
            asm volatile("s_waitcnt vmcnt(0)" ::: "memory");
        } else {
            XB_SPIN(xb_ld(&bar[XB_XGEN(b.x)]) == gen, bar);
            __builtin_amdgcn_fence(__ATOMIC_ACQUIRE, "agent");
            asm volatile("s_waitcnt vmcnt(0)" ::: "memory");
        }
    }
    __syncthreads();
}

struct Params { const float* in[27]; float* out; unsigned char* ws; int ph_lo, ph_hi; };
enum { I_X = 0, I_WIN, I_GMNG, I_GMNB, I_GMWS, I_GMBS, I_CONVW, I_ALOG, I_DTB, I_GDNNG, I_MLIB, I_MLFB, I_MLNG, I_WBR, I_WOUT, I_LN1G, I_LN1B,
       I_WR, I_RB, I_WG, I_WU, I_WD, I_SG, I_SU, I_SD, I_LN2G, I_LN2B };

using pg8::f32x4; using pg8::u32x4; using pg8::Unit; using pg8::HALF; using pg8::BM;

struct MergeOrder {
    int G, c;
    __device__ bool next(int i, Unit& u) const {
        const long L = (long)(i >> 2) * G + c; if (L >= 256) return false;
        const int g = i & 3; int wgid = (int)L; { const int q = 256 / 8, xcd = wgid % 8, off = wgid / 8; wgid = xcd * q + off; }
        const int nN = 8, nig = 8 * nN, gid = wgid / nig, fm = gid * 8; const int pm = fm + ((wgid % nig) % 8), pn = (wgid % nig) / 8;
        u.pm = g * 32 + pm; u.pn = g * 8 + pn; return true;
    }
    __device__ __forceinline__ void a_ready(const Unit&) const {}
    __device__ __forceinline__ void done(const Unit&) const {}
};
struct EpiMerge {
    static constexpr bool PERM = true, AFTER_DRAIN = false;
    const bf16* Z; float* tmp; bf16* msum;
    __device__ __forceinline__ void operator()(const f32x4 (&acc)[2][2][4][2], const Unit& u, int wr, int wc, int fr, int fq) const {
        const int g = u.pm >> 5, pm = u.pm & 31, pn = u.pn & 7;
        const int row0 = pm * BM + wr * 64 + fr, col0 = pn * BM + wc * 32 + 8 * fq;
#pragma unroll
        for (int ai = 0; ai < 2; ++ai)
#pragma unroll
            for (int m = 0; m < 4; ++m) { const size_t row = (size_t)(row0 + ai * HALF + m * 16);
#pragma unroll
                for (int bj = 0; bj < 2; ++bj) { const int col = col0 + bj * HALF;
                    const v4u gr = *(const v4u*)(Z + row * ZC + ZC_GATE + g * D + col); float gl[8]; unpack8(gr, gl);
                    float* tp = tmp + row * D + col; f32x4 v0 = acc[ai][bj][m][0], v1 = acc[ai][bj][m][1];
#pragma unroll
                    for (int j = 0; j < 4; ++j) { v0[j] *= sigmoidf_(gl[j]); v1[j] *= sigmoidf_(gl[4 + j]); }
                    if (g > 0) { v0 += *(const f32x4*)tp; v1 += *(const f32x4*)(tp + 4); }
                    if (g < 3) { *(f32x4*)tp = v0; *(f32x4*)(tp + 4) = v1; }
                    else { u32x4 w; w.x = pk2(v0[0], v0[1]); w.y = pk2(v0[2], v0[3]); w.z = pk2(v1[0], v1[1]); w.w = pk2(v1[2], v1[3]); *(u32x4*)(msum + row * D + col) = w; } }
                asm volatile("" ::: "memory"); }
    }
};
struct EpiResid {
    static constexpr bool PERM = false, AFTER_DRAIN = false;
    const float* X; float* Y;
    __device__ __forceinline__ void operator()(const f32x4 (&acc)[2][2][4][2], const Unit& u, int wr, int wc, int fr, int fq) const {
        const int row0 = u.pm * BM + wr * 64 + fr, col0 = u.pn * BM + wc * 32 + 4 * fq;
#pragma unroll
        for (int ai = 0; ai < 2; ++ai)
#pragma unroll
            for (int m = 0; m < 4; ++m) { const size_t off = (size_t)(row0 + ai * HALF + m * 16) * D + col0;
#pragma unroll
                for (int bj = 0; bj < 2; ++bj)
#pragma unroll
                    for (int n = 0; n < 2; ++n) { const f32x4 xv = *(const f32x4*)(X + off + bj * HALF + n * 16); *(f32x4*)(Y + off + bj * HALF + n * 16) = xv * ALPHA + acc[ai][bj][m][n]; } }
    }
};
struct MoeTab {
    LAS int* t; LAS unsigned short* tok; LAS float* wt; LAS unsigned char* mte;
    __device__ __forceinline__ MoeTab(LAS unsigned char* lds) : t((LAS int*)(lds + TAB_OFF)), tok((LAS unsigned short*)(lds + TAB_OFF + 1024)), wt((LAS float*)(lds + TAB_OFF + 5120)), mte((LAS unsigned char*)(lds + TAB_OFF + 13312)) {}
};
__device__ __forceinline__ void moe_tables(const MoeTab& M, const unsigned* cnt  , int tid, int lane, int wave) {
    __syncthreads();
    if (wave == 0) { const int c = (int)cnt[64 * lane]; const int tiles = (c + 255) >> 8; const float incl = wave_scan_incl((float)tiles);
        M.t[80 + lane] = c; M.t[lane] = (int)incl - tiles; if (lane == 63) { M.t[64] = (int)incl; M.t[65] = (int)incl + T / 256; M.t[80 + 64] = T; } }
    __syncthreads();
    const int Mt = M.t[65];
    for (int mt = tid; mt < Mt; mt += 512) { int e = 0;
        for (int k = 1; k <= 64; ++k) e = (M.t[k] <= mt) ? k : e;
        M.mte[mt] = (unsigned char)e; }
    __syncthreads();
}
struct UpOrder {
    MoeTab M; int n;
    __device__ __forceinline__ bool next(int i, Unit& u) const { if (i >= n) return false; u.pm = M.t[168 + i]; u.pn = M.t[176 + i]; u.aux = i; return true; }
    __device__ __forceinline__ int row_token(int i, int r) const { return (int)M.tok[i * 256 + r]; }
    __device__ __forceinline__ void a_ready(const Unit&) const {}
    __device__ __forceinline__ void done(const Unit&) const {}
};
__device__ __forceinline__ int up_order_build(const MoeTab& M, const int* LIST, const float* WL, int wg, int G, int tid) {
    const int U = 4 * M.t[65];
    if (tid < 8) { const int L = tid * G + wg; if (L < U) { const int mt = L >> 2, q = L & 3, e = M.mte[mt]; M.t[168 + tid] = mt; M.t[176 + tid] = e * 4 + q; M.t[184 + tid] = e; M.t[192 + tid] = mt - M.t[e]; } }
    int n = 0;
#pragma unroll
    for (int i = 0; i < 8; ++i) n += (i * G + wg < U) ? 1 : 0;
    __syncthreads();
    for (int idx = tid; idx < n * 256; idx += 512) { const int i = idx >> 8, r = idx & 255, e = M.t[184 + i], li = M.t[192 + i] * 256 + r;
        int tk = 0; float w = 0.f;
        if (e < NE) { if (li < M.t[80 + e]) { tk = LIST[e * T + li]; w = WL[e * T + li]; } } else { tk = li; w = 1.f; }
        M.tok[idx] = (unsigned short)tk; M.wt[idx] = w; }
    __syncthreads();
    return n;
}
struct EpiGluSparse {
    static constexpr bool PERM = true, AFTER_DRAIN = false;
    LAS const float* wt; bf16* H;
    __device__ __forceinline__ void operator()(const f32x4 (&acc)[2][2][4][2], const Unit& u, int wr, int wc, int fr, int fq) const {
        const int q = u.pn & 3; const int rl0 = wr * 64 + fr, col0 = q * 128 + wc * 32 + 8 * fq;
#pragma unroll
        for (int ai = 0; ai < 2; ++ai)
#pragma unroll
            for (int m = 0; m < 4; ++m) { const int rl = rl0 + ai * HALF + m * 16; const float c = wt[u.aux * 256 + rl]; float h[8];
#pragma unroll
                for (int n = 0; n < 2; ++n)
#pragma unroll
                    for (int j = 0; j < 4; ++j) h[4 * n + j] = siluf_(acc[ai][0][m][n][j] * UPSC) * (acc[ai][1][m][n][j] * UPSC) * c;
                u32x4 w; w.x = pk2(h[0], h[1]); w.y = pk2(h[2], h[3]); w.z = pk2(h[4], h[5]); w.w = pk2(h[6], h[7]);
                *(u32x4*)(H + ((size_t)u.pm * 256 + rl) * ED + col0) = w; }
    }
};
struct DownOrder {
    MoeTab M; int G, c, U;
    __device__ __forceinline__ bool next(int i, Unit& u) const { const int L = i * G + c; if (L >= U) return false; const int mt = L >> 3; u.pm = mt; u.pn = (int)M.mte[mt] * 8 + (L & 7); u.aux = 0; return true; }
    __device__ __forceinline__ void a_ready(const Unit&) const {}
    __device__ __forceinline__ void done(const Unit&) const {}
};
struct EpiYexp {
    static constexpr bool PERM = true, AFTER_DRAIN = false;
    bf16* Y;
    __device__ __forceinline__ void operator()(const f32x4 (&acc)[2][2][4][2], const Unit& u, int wr, int wc, int fr, int fq) const {
        const int row0 = u.pm * BM + wr * 64 + fr, col0 = (u.pn & 7) * BM + wc * 32 + 8 * fq;
#pragma unroll
        for (int ai = 0; ai < 2; ++ai)
#pragma unroll
            for (int m = 0; m < 4; ++m) { bf16* rowp = Y + (size_t)(row0 + ai * HALF + m * 16) * D + col0;
#pragma unroll
                for (int bj = 0; bj < 2; ++bj) { const f32x4 v0 = acc[ai][bj][m][0], v1 = acc[ai][bj][m][1];
                    u32x4 w; w.x = pk2(v0[0], v0[1]); w.y = pk2(v0[2], v0[3]); w.z = pk2(v1[0], v1[1]); w.w = pk2(v1[2], v1[3]); *(u32x4*)(rowp + bj * HALF) = w; } }
    }
};

struct TrItem { const float* src; bf16* dst; unsigned sld, dld; int f8; };
__device__ __forceinline__ void tr_load(const TrItem& t, int lane, v4f (&v)[8]) { const int r8 = lane >> 3, c4 = lane & 7;
#pragma unroll
    for (int i = 0; i < 8; ++i) v[i] = *(const v4f*)(t.src + (size_t)(8 * i + r8) * t.sld + 4 * c4); }
__device__ __forceinline__ void tr_store(const TrItem& t, const v4f (&v)[8], LAS float* scr, int lane) {
    { const int r8 = lane >> 3, c4 = lane & 7;
#pragma unroll
      for (int i = 0; i < 8; ++i) { LAS float* d = scr + (8 * i + r8) * 33 + 4 * c4; d[0] = v[i].x; d[1] = v[i].y; d[2] = v[i].z; d[3] = v[i].w; } }
    LDS_WAIT(); asm volatile("" ::: "memory");
    if (t.f8) {
        const int c = lane & 3;
#pragma unroll
        for (int j = 0; j < 2; ++j) { const int n = (lane >> 2) + 16 * j; const LAS float* s = scr + (16 * c) * 33 + n; unsigned w[4];
#pragma unroll
            for (int q = 0; q < 4; ++q) { unsigned x = 0; x = __builtin_amdgcn_cvt_pk_fp8_f32(s[(4 * q) * 33] * 64.f, s[(4 * q + 1) * 33] * 64.f, x, false); x = __builtin_amdgcn_cvt_pk_fp8_f32(s[(4 * q + 2) * 33] * 64.f, s[(4 * q + 3) * 33] * 64.f, x, true); w[q] = x; }
            *(v4u*)((unsigned char*)t.dst + (size_t)n * t.dld + 16 * c) = (v4u){w[0], w[1], w[2], w[3]}; }
    } else {
        const int c = lane & 7;
#pragma unroll
        for (int j = 0; j < 4; ++j) { const int n = (lane >> 3) + 8 * j; const LAS float* s = scr + (8 * c) * 33 + n;
            v4u o; o.x = pk2(s[0 * 33], s[1 * 33]); o.y = pk2(s[2 * 33], s[3 * 33]); o.z = pk2(s[4 * 33], s[5 * 33]); o.w = pk2(s[6 * 33], s[7 * 33]);
            *(v4u*)(t.dst + (size_t)n * t.dld + 8 * c) = o; }
    }
    LDS_WAIT(); asm volatile("" ::: "memory");
}
template <int PART> __device__ __forceinline__ TrItem tr_decode(const Params& p, int l, int it) {
    unsigned char* ws = p.ws;
    constexpr int N_IN = (ZC / 32) * (D / 64), N_BR = 4 * (BW / 64) * (D / 32), N_OUT = (D / 64) * (D / 32), N_UP = NEX * 2 * (D / 64) * (ED / 32);
    int r = it; TrItem t; t.f8 = 0;
    if (PART == 0) {
        const float* w_in = p.in[I_WIN] + (size_t)l * D * INC; const float* w_br = p.in[I_WBR] + (size_t)l * 4 * BW * D; const float* w_out = p.in[I_WOUT] + (size_t)l * D * D;
        bf16* WIN = (bf16*)(ws + WS_WIN); bf16* WBR = (bf16*)(ws + WS_WBR); bf16* WOUT = (bf16*)(ws + WS_WOUT);
        if (r < N_IN) { const int kb = r / (ZC / 32), n0 = (r % (ZC / 32)) * 32, k0 = kb * 64; const int sc = n0 + (n0 >= ZC_GATE ? 16 : (n0 >= ZC_MLQ ? 8 : 0));
            t.src = w_in + (size_t)k0 * INC + sc; t.sld = INC; t.dst = (bf16*)((unsigned char*)WIN + (size_t)n0 * D + k0); t.dld = D; t.f8 = 1; return t; } r -= N_IN;
        if (r < N_BR) { const int g = r / 512, rr = r % 512, k0 = (rr / 64) * 64, n0 = (rr % 64) * 32;
            t.src = w_br + ((size_t)g * BW + k0) * D + n0; t.sld = D; t.dst = WBR + ((size_t)g * D + n0) * BW + k0; t.dld = BW; return t; } r -= N_BR;
        { const int k0 = (r / 64) * 64, n0 = (r % 64) * 32; t.src = w_out + (size_t)k0 * D + n0; t.sld = D; t.dst = WOUT + (size_t)n0 * D + k0; t.dld = D; return t; }
    } else {
        const float* w_g = p.in[I_WG] + (size_t)l * NE * D * ED; const float* w_u = p.in[I_WU] + (size_t)l * NE * D * ED; const float* w_d = p.in[I_WD] + (size_t)l * NE * ED * D;
        const float* s_g = p.in[I_SG] + (size_t)l * D * ED; const float* s_u = p.in[I_SU] + (size_t)l * D * ED; const float* s_d = p.in[I_SD] + (size_t)l * ED * D;
        bf16* WUP = (bf16*)(ws + WS_WUP); bf16* WDN = (bf16*)(ws + WS_WDN);
        if (r < N_UP) { const int e = r / 1024, rr = r % 1024, mat = rr / 512, r2 = rr % 512, k0 = (r2 / 16) * 64, n0 = (r2 % 16) * 32;
            const float* sb = (e < NE) ? ((mat ? w_u : w_g) + (size_t)e * D * ED) : (mat ? s_u : s_g);
            const int drow = e * 1024 + (n0 / 128) * 256 + mat * 128 + (n0 % 128);
            t.src = sb + (size_t)k0 * ED + n0; t.sld = ED;
#if MOE_UP_FP8
            t.dst = (bf16*)((unsigned char*)WUP + (size_t)drow * D + k0); t.dld = D; t.f8 = 1; return t; }
#else
            t.dst = WUP + (size_t)drow * D + k0; t.dld = D; return t; }
#endif
        r -= N_UP;
        { const int e = r / 512, rr = r % 512, k0 = (rr / 64) * 64, n0 = (rr % 64) * 32;
            const float* sb = (e < NE) ? (w_d + (size_t)e * ED * D) : s_d;
            t.src = sb + (size_t)k0 * D + n0; t.sld = D; t.dst = WDN + ((size_t)e * D + n0) * ED + k0; t.dld = ED; return t; }
    }
}
template <int PART> __device__ __forceinline__ void phase_convert(const Params& p, int l, LAS unsigned char* lds, int gw, int NGW, int wave, int lane) {
    constexpr int N_IN = (ZC / 32) * (D / 64), N_BR = 4 * (BW / 64) * (D / 32), N_OUT = (D / 64) * (D / 32), N_UP = NEX * 2 * (D / 64) * (ED / 32), N_DN = NEX * (ED / 64) * (D / 32);
    constexpr int NITEMS = (PART == 0) ? (N_IN + N_BR + N_OUT) : (N_UP + N_DN);
    LAS float* scr = (LAS float*)(lds + wave * 16384);
    if (gw >= NITEMS) return;
    TrItem cur = tr_decode<PART>(p, l, gw); v4f va[8], vb[8];
    tr_load(cur, lane, va);
    for (int it = gw; it < NITEMS; it += 2 * NGW) {
        const int i1 = it + NGW, i2 = it + 2 * NGW; TrItem nx = cur;
        if (i1 < NITEMS) { nx = tr_decode<PART>(p, l, i1); } tr_load(nx, lane, vb);
        tr_store(cur, va, scr, lane);
        if (i1 >= NITEMS) break;
        cur = nx; if (i2 < NITEMS) { cur = tr_decode<PART>(p, l, i2); } tr_load(cur, lane, va);
        tr_store(nx, vb, scr, lane);
        if (i2 >= NITEMS) break;
    }
}
__device__ __forceinline__ void phase_xprep(const Params& p, int l, const float* xin, LAS unsigned char* lds, int gw, int NGW, int tid, int lane) {
    const float* w_in = p.in[I_WIN] + (size_t)l * D * INC; LAS float* wsm = (LAS float*)lds;
    __syncthreads();
    for (int idx = tid; idx < D * 16; idx += 512) { const int d = idx >> 4, c = idx & 15; wsm[c * D + d] = w_in[(size_t)d * INC + (c < 8 ? 4608 + c : 6152 + (c - 8))]; }
    __syncthreads();
    bf16* XB = (bf16*)(p.ws + WS_XB); float* SMALL = (float*)(p.ws + WS_SMALL);
    for (int m = gw; m < T; m += NGW) {
        const v4f* xr = (const v4f*)(xin + (size_t)m * D) + lane; v4f v[8];
#pragma unroll
        for (int j = 0; j < 8; ++j) v[j] = xr[64 * j];
        unsigned* xo = (unsigned*)((unsigned char*)XB + (size_t)m * D) + lane;
#pragma unroll
        for (int j = 0; j < 8; ++j) { unsigned w = 0; w = __builtin_amdgcn_cvt_pk_fp8_f32(v[j].x, v[j].y, w, false); w = __builtin_amdgcn_cvt_pk_fp8_f32(v[j].z, v[j].w, w, true); xo[64 * j] = w; }
        float res = 0.f;
#pragma unroll 1
        for (int c = 0; c < 16; ++c) { float a = 0.f;
#pragma unroll
            for (int j = 0; j < 8; ++j) { const v4f w = *(const LAS v4f*)(wsm + c * D + 4 * lane + 256 * j); a += v[j].x * w.x + v[j].y * w.y + v[j].z * w.z + v[j].w * w.w; }
            a = wave_sum(a); if (lane == c) res = a; }
        if (lane < 16) SMALL[(size_t)m * 16 + lane] = res;
    }
    __syncthreads();
}


typedef short bf16x8_t __attribute__((ext_vector_type(8)));
__device__ __forceinline__ void ml_pre_item(const Params& p, int l, LAS unsigned char* lds, int item, int tid, int wave, int lane) {
    const int h = item & 3, n = item >> 2; const size_t t0 = (size_t)n * 64;
    const bf16* Z = (const bf16*)(p.ws + WS_Z); const float* SMALL = (const float*)(p.ws + WS_SMALL);
    bf16* MQ = (bf16*)(p.ws + WS_MQ) + (size_t)item * 4096; bf16* MS = (bf16*)(p.ws + WS_MS) + (size_t)item * 4096; bf16* MK = (bf16*)(p.ws + WS_MK) + (size_t)item * 4096;
    bf16* MV = (bf16*)(p.ws + WS_MV) + (size_t)item * 9216; float* MFL = (float*)(p.ws + WS_MFL);
    LAS float* qs = (LAS float*)lds;
    LAS float* ks = qs + 64 * 65;
    LAS float* bs = ks + 64 * 65;
    LAS unsigned short* vs = (LAS unsigned short*)(bs + 128);
    { const int tk = tid >> 3, c8 = tid & 7; float f[8];
      unpack8(*(const v4u*)(Z + (t0 + tk) * ZC + ZC_MLQ + h * 64 + 8 * c8), f);
#pragma unroll
      for (int i = 0; i < 8; ++i) qs[tk * 65 + 8 * c8 + i] = f[i];
      unpack8(*(const v4u*)(Z + (t0 + tk) * ZC + ZC_MLK + h * 64 + 8 * c8), f);
#pragma unroll
      for (int i = 0; i < 8; ++i) ks[tk * 65 + 8 * c8 + i] = f[i]; }
#pragma unroll
    for (int r = 0; r < 2; ++r) { const int idx = tid + 512 * r, tk = idx >> 4, c8 = idx & 15;
        *(LAS v4u*)(vs + tk * 136 + 8 * c8) = *(const v4u*)(Z + (t0 + tk) * ZC + ZC_MLV + h * 128 + 8 * c8); }
    if (wave == 0) { const float fp = SMALL[(t0 + lane) * 16 + 12 + h] + p.in[I_MLFB][l * 4 + h]; const float lf = -softplusf_(-fp);
        bs[lane] = wave_scan_incl(lf); bs[64 + lane] = SMALL[(t0 + lane) * 16 + 8 + h] + p.in[I_MLIB][l * 4 + h]; }
    __syncthreads();
    const float blast = bs[63];
    { const int i = tid >> 3, jb = tid & 7; const float bi = bs[i];
      { const float e = __expf(bi) * 0.125f; float o[8];
#pragma unroll
        for (int x = 0; x < 8; ++x) o[x] = qs[i * 65 + 8 * jb + x] * e;
        v4u w; w.x = pk2(o[0], o[1]); w.y = pk2(o[2], o[3]); w.z = pk2(o[4], o[5]); w.w = pk2(o[6], o[7]); *(v4u*)(MQ + i * 64 + 8 * jb) = w; }
      { float d[8];
#pragma unroll
        for (int x = 0; x < 8; ++x) d[x] = 0.f;
        if (8 * jb <= i) {
            for (int dd = 0; dd < 64; ++dd) { const float qv = qs[i * 65 + dd];
#pragma unroll
                for (int x = 0; x < 8; ++x) d[x] += qv * ks[(8 * jb + x) * 65 + dd]; }
#pragma unroll
            for (int x = 0; x < 8; ++x) { const int j = 8 * jb + x; d[x] = (j <= i) ? __expf(bi - bs[j] + bs[64 + j]) * d[x] * 0.125f : 0.f; } }
        v4u w; w.x = pk2(d[0], d[1]); w.y = pk2(d[2], d[3]); w.z = pk2(d[4], d[5]); w.w = pk2(d[6], d[7]); *(v4u*)(MS + i * 64 + 8 * jb) = w; }
      { float o[8];
#pragma unroll
        for (int x = 0; x < 8; ++x) { const int j = 8 * jb + x; o[x] = ks[j * 65 + i] * __expf(blast - bs[j] + bs[64 + j]); }
        v4u w; w.x = pk2(o[0], o[1]); w.y = pk2(o[2], o[3]); w.z = pk2(o[4], o[5]); w.w = pk2(o[6], o[7]); *(v4u*)(MK + i * 64 + 8 * jb) = w; }
    }
    { const int c = tid >> 2, jq = tid & 3; unsigned w[8];
#pragma unroll
      for (int x = 0; x < 8; ++x) w[x] = (unsigned)vs[(16 * jq + 2 * x) * 136 + c] | ((unsigned)vs[(16 * jq + 2 * x + 1) * 136 + c] << 16);
      *(v4u*)(MV + c * 64 + 16 * jq) = (v4u){w[0], w[1], w[2], w[3]}; *(v4u*)(MV + c * 64 + 16 * jq + 8) = (v4u){w[4], w[5], w[6], w[7]};
      if (tid < 64) { const int c2 = 128 + (tid >> 2); const unsigned one = (c2 == 128) ? 0x3F803F80u : 0u;
          *(v4u*)(MV + c2 * 64 + 16 * jq) = (v4u){one, one, one, one}; *(v4u*)(MV + c2 * 64 + 16 * jq + 8) = (v4u){one, one, one, one}; } }
    if (tid == 0) MFL[item] = __expf(blast);
    __syncthreads();
}
struct MlFrags { bf16x8_t q[2], s[2], kt[2], vt[2]; float fl; };
__device__ __forceinline__ void ml_load(MlFrags& F, const Params& p, int item, int offA, int offV) {
    const bf16* MQ = (const bf16*)(p.ws + WS_MQ) + (size_t)item * 4096; const bf16* MS = (const bf16*)(p.ws + WS_MS) + (size_t)item * 4096; const bf16* MK = (const bf16*)(p.ws + WS_MK) + (size_t)item * 4096;
    const bf16* MV = (const bf16*)(p.ws + WS_MV) + (size_t)item * 9216;
#pragma unroll
    for (int ks = 0; ks < 2; ++ks) { F.q[ks] = *(const bf16x8_t*)(MQ + offA + 32 * ks); F.s[ks] = *(const bf16x8_t*)(MS + offA + 32 * ks); F.kt[ks] = *(const bf16x8_t*)(MK + offA + 32 * ks); F.vt[ks] = *(const bf16x8_t*)(MV + offV + 32 * ks); }
    F.fl = ((const float*)(p.ws + WS_MFL))[item];
}
__device__ __forceinline__ void ml_seq(const Params& p, LAS unsigned char* lds, int wgi, int wave, int lane) {
    const int u = wgi * 2 + (wave >> 2), wi = wave & 3, h = u / 9, sl = u % 9, g = lane >> 4, c = lane & 15;
    LAS unsigned short* CT = (LAS unsigned short*)(lds + (wave >> 2) * 4096);
    float* HO = (float*)(p.ws + WS_HO); float* HDEN = (float*)(p.ws + WS_HDEN);
    const int offA = (16 * wi + c) * 64 + 8 * g, offV = (16 * sl + c) * 64 + 8 * g;
    *(LAS v2u*)(CT + c * 64 + 16 * wi + 4 * g) = (v2u){0u, 0u};
    pg8::f32x4 Cacc = {0.f, 0.f, 0.f, 0.f};
    __syncthreads();
    MlFrags F0, F1;
    ml_load(F0, p, h, offA, offV);
#define ML_STEP(F, n_) do { const int cur = (n_) & 1; \
        const bf16x8_t c0 = *(const LAS bf16x8_t*)(CT + cur * 1024 + c * 64 + 8 * g), c1 = *(const LAS bf16x8_t*)(CT + cur * 1024 + c * 64 + 32 + 8 * g); \
        pg8::f32x4 num = {0.f, 0.f, 0.f, 0.f}; \
        num = __builtin_amdgcn_mfma_f32_16x16x32_bf16(F.q[0], c0, num, 0, 0, 0); num = __builtin_amdgcn_mfma_f32_16x16x32_bf16(F.q[1], c1, num, 0, 0, 0); \
        num = __builtin_amdgcn_mfma_f32_16x16x32_bf16(F.s[0], F.vt[0], num, 0, 0, 0); num = __builtin_amdgcn_mfma_f32_16x16x32_bf16(F.s[1], F.vt[1], num, 0, 0, 0); \
        Cacc = Cacc * F.fl; \
        Cacc = __builtin_amdgcn_mfma_f32_16x16x32_bf16(F.kt[0], F.vt[0], Cacc, 0, 0, 0); Cacc = __builtin_amdgcn_mfma_f32_16x16x32_bf16(F.kt[1], F.vt[1], Cacc, 0, 0, 0); \
        { v2u w; w.x = pk2(Cacc[0], Cacc[1]); w.y = pk2(Cacc[2], Cacc[3]); *(LAS v2u*)(CT + (cur ^ 1) * 1024 + c * 64 + 16 * wi + 4 * g) = w; } \
        { const size_t tb = (size_t)(n_) * 64 + 16 * wi + 4 * g; \
          if (sl < 8) { _Pragma("unroll") for (int r = 0; r < 4; ++r) HO[(tb + r) * BW + h * 128 + 16 * sl + c] = num[r]; } \
          else if (c == 0) { _Pragma("unroll") for (int r = 0; r < 4; ++r) HDEN[(tb + r) * 4 + h] = num[r]; } } \
        LDS_BAR(); } while (0)
    for (int n = 0; n < T / 64; n += 2) {
        ml_load(F1, p, (n + 1) * 4 + h, offA, offV);
        ML_STEP(F0, n);
        ml_load(F0, p, ((n + 2 < T / 64) ? n + 2 : n) * 4 + h, offA, offV);
        ML_STEP(F1, n + 1);
    }
#undef ML_STEP
}


constexpr int QP = 132;
__device__ __forceinline__ void gdn_pre_item(const Params& p, int l, LAS unsigned char* lds, int item, int tid, int wave, int lane) {
    const int h = item & 3, n = item >> 2; const size_t t0 = (size_t)n * 64;
    const bf16* Z = (const bf16*)(p.ws + WS_Z); const float* SMALL = (const float*)(p.ws + WS_SMALL);
    float* GU = (float*)(p.ws + WS_GU) + (size_t)item * 8192; bf16* GNW = (bf16*)(p.ws + WS_GNW) + (size_t)item * 8192; bf16* GQG = (bf16*)(p.ws + WS_GQG) + (size_t)item * 8192;
    bf16* GAT = (bf16*)(p.ws + WS_GAT) + (size_t)item * 4096; bf16* GKT = (bf16*)(p.ws + WS_GKT) + (size_t)item * 8192; float* GDL = (float*)(p.ws + WS_GDL);
    const float* cw = p.in[I_CONVW] + (size_t)l * 4 * 1536;
    LAS float* qs = (LAS float*)lds; LAS float* ks = qs + 64 * QP; LAS float* vs = ks + 64 * QP; LAS float* Ls = vs + 64 * QP;   LAS float* gcs = Ls + 64 * 68; LAS float* bts = gcs + 64; LAS float* btg = bts + 64;
    { const int tk = tid >> 3, part = tid & 7;
#pragma unroll 1
      for (int i = 0; i < 3; ++i) { float a[16];
#pragma unroll
        for (int x = 0; x < 16; ++x) a[x] = 0.f;
#pragma unroll
        for (int j = 0; j < 4; ++j) { const long tt = (long)t0 + tk - 3 + j; if (tt >= 0) {
            const bf16* src = Z + (size_t)tt * ZC + ZC_GDN + i * 512 + h * 128 + 16 * part; float x0[8], x1[8]; unpack8(*(const v4u*)src, x0); unpack8(*(const v4u*)(src + 8), x1);
            const float* wp = cw + j * 1536 + i * 512 + h * 128 + 16 * part;
#pragma unroll
            for (int x = 0; x < 8; ++x) { a[x] += wp[x] * x0[x]; a[8 + x] += wp[8 + x] * x1[x]; } } }
        float ss = 0.f;
#pragma unroll
        for (int x = 0; x < 16; ++x) { a[x] = siluf_(a[x]); ss += a[x] * a[x]; }
        if (i < 2) { ss = sum8(ss); const float r = rsqrtf(ss + 1e-6f) * (i == 0 ? 0.08838834764831845f : 1.f);
#pragma unroll
            for (int x = 0; x < 16; ++x) a[x] *= r; }
        LAS float* dst = (i == 0 ? qs : (i == 1 ? ks : vs)) + tk * QP + 16 * part;
#pragma unroll
        for (int x4 = 0; x4 < 4; ++x4) *(LAS v4f*)(dst + 4 * x4) = (v4f){a[4 * x4], a[4 * x4 + 1], a[4 * x4 + 2], a[4 * x4 + 3]}; } }
    if (wave == 0) { const float bb = SMALL[(t0 + lane) * 16 + h], aa = SMALL[(t0 + lane) * 16 + 4 + h];
        const float g = -__expf(p.in[I_ALOG][l * 4 + h]) * softplusf_(aa + p.in[I_DTB][l * 4 + h]);
        const float gc = wave_scan_incl(g), bt = sigmoidf_(bb); gcs[lane] = gc; bts[lane] = bt; btg[lane] = bt * __expf(gc); }
    __syncthreads();
    { const int i = tid >> 3, jb = tid & 7; const float gi = gcs[i], bi = bts[i]; float dk[8], dq[8];
#pragma unroll
      for (int x = 0; x < 8; ++x) { dk[x] = 0.f; dq[x] = 0.f; }
      if (8 * jb <= i) {
#pragma unroll 2
          for (int d4 = 0; d4 < 32; ++d4) { const v4f qi = *(const LAS v4f*)(qs + i * QP + 4 * d4), ki = *(const LAS v4f*)(ks + i * QP + 4 * d4);
#pragma unroll
              for (int x = 0; x < 8; ++x) { const v4f kj = *(const LAS v4f*)(ks + (8 * jb + x) * QP + 4 * d4);
                  dk[x] += ki.x * kj.x + ki.y * kj.y + ki.z * kj.z + ki.w * kj.w; dq[x] += qi.x * kj.x + qi.y * kj.y + qi.z * kj.z + qi.w * kj.w; } }
#pragma unroll
          for (int x = 0; x < 8; ++x) { const int j = 8 * jb + x; const float dc = __expf(gi - gcs[j]); dk[x] = (j < i) ? bi * dk[x] * dc : 0.f; dq[x] = (j <= i) ? dq[x] * dc : 0.f; } }
      *(LAS v4f*)(Ls + i * 68 + 8 * jb) = (v4f){dk[0], dk[1], dk[2], dk[3]}; *(LAS v4f*)(Ls + i * 68 + 8 * jb + 4) = (v4f){dk[4], dk[5], dk[6], dk[7]};
      v4u w; w.x = pk2(dq[0], dq[1]); w.y = pk2(dq[2], dq[3]); w.z = pk2(dq[4], dq[5]); w.w = pk2(dq[6], dq[7]); *(v4u*)(GAT + i * 64 + 8 * jb) = w; }
    __syncthreads();
    if (tid < 256) {
        const int c = tid; int vz; asm volatile("v_mov_b32 %0, 0" : "=v"(vz));
        const LAS float* rp = (c < 128) ? (vs + c) : (ks + (c - 128)); const LAS float* mp = ((c < 128) ? bts : btg) + vz;
#define GDN_RHS(i) (rp[(i) * QP] * mp[(i)])
#define GDN_L4(i, j4) (*(const LAS v4f*)(Ls + (i) * 68 + 4 * (j4) + vz))
        float x0 = GDN_RHS(0); __builtin_amdgcn_sched_barrier(0);
        float x1 = GDN_RHS(1); { const v4f l = GDN_L4(1, 0); x1 -= l.x * x0; } __builtin_amdgcn_sched_barrier(0);
        float x2 = GDN_RHS(2); { const v4f l = GDN_L4(2, 0); x2 -= l.x * x0; x2 -= l.y * x1; } __builtin_amdgcn_sched_barrier(0);
        float x3 = GDN_RHS(3); { const v4f l = GDN_L4(3, 0); x3 -= l.x * x0; x3 -= l.y * x1; x3 -= l.z * x2; } __builtin_amdgcn_sched_barrier(0);
        float x4 = GDN_RHS(4); { const v4f l = GDN_L4(4, 0); x4 -= l.x * x0; x4 -= l.y * x1; x4 -= l.z * x2; x4 -= l.w * x3; } __builtin_amdgcn_sched_barrier(0);
        float x5 = GDN_RHS(5); { const v4f l = GDN_L4(5, 0); x5 -= l.x * x0; x5 -= l.y * x1; x5 -= l.z * x2; x5 -= l.w * x3; } { const v4f l = GDN_L4(5, 1); x5 -= l.x * x4; } __builtin_amdgcn_sched_barrier(0);
        float x6 = GDN_RHS(6); { const v4f l = GDN_L4(6, 0); x6 -= l.x * x0; x6 -= l.y * x1; x6 -= l.z * x2; x6 -= l.w * x3; } { const v4f l = GDN_L4(6, 1); x6 -= l.x * x4; x6 -= l.y * x5; } __builtin_amdgcn_sched_barrier(0);
        float x7 = GDN_RHS(7); { const v4f l = GDN_L4(7, 0); x7 -= l.x * x0; x7 -= l.y * x1; x7 -= l.z * x2; x7 -= l.w * x3; } { const v4f l = GDN_L4(7, 1); x7 -= l.x * x4; x7 -= l.y * x5; x7 -= l.z * x6; } __builtin_amdgcn_sched_barrier(0);
        float x8 = GDN_RHS(8); { const v4f l = GDN_L4(8, 0); x8 -= l.x * x0; x8 -= l.y * x1; x8 -= l.z * x2; x8 -= l.w * x3; } { const v4f l = GDN_L4(8, 1); x8 -= l.x * x4; x8 -= l.y * x5; x8 -= l.z * x6; x8 -= l.w * x7; } __builtin_amdgcn_sched_barrier(0);
        float x9 = GDN_RHS(9); { const v4f l = GDN_L4(9, 0); x9 -= l.x * x0; x9 -= l.y * x1; x9 -= l.z * x2; x9 -= l.w * x3; } { const v4f l = GDN_L4(9, 1); x9 -= l.x * x4; x9 -= l.y * x5; x9 -= l.z * x6; x9 -= l.w * x7; } { const v4f l = GDN_L4(9, 2); x9 -= l.x * x8; } __builtin_amdgcn_sched_barrier(0);
        float x10 = GDN_RHS(10); { const v4f l = GDN_L4(10, 0); x10 -= l.x * x0; x10 -= l.y * x1; x10 -= l.z * x2; x10 -= l.w * x3; } { const v4f l = GDN_L4(10, 1); x10 -= l.x * x4; x10 -= l.y * x5; x10 -= l.z * x6; x10 -= l.w * x7; } { const v4f l = GDN_L4(10, 2); x10 -= l.x * x8; x10 -= l.y * x9; } __builtin_amdgcn_sched_barrier(0);
        float x11 = GDN_RHS(11); { const v4f l = GDN_L4(11, 0); x11 -= l.x * x0; x11 -= l.y * x1; x11 -= l.z * x2; x11 -= l.w * x3; } { const v4f l = GDN_L4(11, 1); x11 -= l.x * x4; x11 -= l.y * x5; x11 -= l.z * x6; x11 -= l.w * x7; } { const v4f l = GDN_L4(11, 2); x11 -= l.x * x8; x11 -= l.y * x9; x11 -= l.z * x10; } __builtin_amdgcn_sched_barrier(0);
        float x12 = GDN_RHS(12); { const v4f l = GDN_L4(12, 0); x12 -= l.x * x0; x12 -= l.y * x1; x12 -= l.z * x2; x12 -= l.w * x3; } { const v4f l = GDN_L4(12, 1); x12 -= l.x * x4; x12 -= l.y * x5; x12 -= l.z * x6; x12 -= l.w * x7; } { const v4f l = GDN_L4(12, 2); x12 -= l.x * x8; x12 -= l.y * x9; x12 -= l.z * x10; x12 -= l.w * x11; } __builtin_amdgcn_sched_barrier(0);
        float x13 = GDN_RHS(13); { const v4f l = GDN_L4(13, 0); x13 -= l.x * x0; x13 -= l.y * x1; x13 -= l.z * x2; x13 -= l.w * x3; } { const v4f l = GDN_L4(13, 1); x13 -= l.x * x4; x13 -= l.y * x5; x13 -= l.z * x6; x13 -= l.w * x7; } { const v4f l = GDN_L4(13, 2); x13 -= l.x * x8; x13 -= l.y * x9; x13 -= l.z * x10; x13 -= l.w * x11; } { const v4f l = GDN_L4(13, 3); x13 -= l.x * x12; } __builtin_amdgcn_sched_barrier(0);
        float x14 = GDN_RHS(14); { const v4f l = GDN_L4(14, 0); x14 -= l.x * x0; x14 -= l.y * x1; x14 -= l.z * x2; x14 -= l.w * x3; } { const v4f l = GDN_L4(14, 1); x14 -= l.x * x4; x14 -= l.y * x5; x14 -= l.z * x6; x14 -= l.w * x7; } { const v4f l = GDN_L4(14, 2); x14 -= l.x * x8; x14 -= l.y * x9; x14 -= l.z * x10; x14 -= l.w * x11; } { const v4f l = GDN_L4(14, 3); x14 -= l.x * x12; x14 -= l.y * x13; } __builtin_amdgcn_sched_barrier(0);
        float x15 = GDN_RHS(15); { const v4f l = GDN_L4(15, 0); x15 -= l.x * x0; x15 -= l.y * x1; x15 -= l.z * x2; x15 -= l.w * x3; } { const v4f l = GDN_L4(15, 1); x15 -= l.x * x4; x15 -= l.y * x5; x15 -= l.z * x6; x15 -= l.w * x7; } { const v4f l = GDN_L4(15, 2); x15 -= l.x * x8; x15 -= l.y * x9; x15 -= l.z * x10; x15 -= l.w * x11; } { const v4f l = GDN_L4(15, 3); x15 -= l.x * x12; x15 -= l.y * x13; x15 -= l.z * x14; } __builtin_amdgcn_sched_barrier(0);
        float x16 = GDN_RHS(16); { const v4f l = GDN_L4(16, 0); x16 -= l.x * x0; x16 -= l.y * x1; x16 -= l.z * x2; x16 -= l.w * x3; } { const v4f l = GDN_L4(16, 1); x16 -= l.x * x4; x16 -= l.y * x5; x16 -= l.z * x6; x16 -= l.w * x7; } { const v4f l = GDN_L4(16, 2); x16 -= l.x * x8; x16 -= l.y * x9; x16 -= l.z * x10; x16 -= l.w * x11; } { const v4f l = GDN_L4(16, 3); x16 -= l.x * x12; x16 -= l.y * x13; x16 -= l.z * x14; x16 -= l.w * x15; } __builtin_amdgcn_sched_barrier(0);
        float x17 = GDN_RHS(17); { const v4f l = GDN_L4(17, 0); x17 -= l.x * x0; x17 -= l.y * x1; x17 -= l.z * x2; x17 -= l.w * x3; } { const v4f l = GDN_L4(17, 1); x17 -= l.x * x4; x17 -= l.y * x5; x17 -= l.z * x6; x17 -= l.w * x7; } { const v4f l = GDN_L4(17, 2); x17 -= l.x * x8; x17 -= l.y * x9; x17 -= l.z * x10; x17 -= l.w * x11; } { const v4f l = GDN_L4(17, 3); x17 -= l.x * x12; x17 -= l.y * x13; x17 -= l.z * x14; x17 -= l.w * x15; } { const v4f l = GDN_L4(17, 4); x17 -= l.x * x16; } __builtin_amdgcn_sched_barrier(0);
        float x18 = GDN_RHS(18); { const v4f l = GDN_L4(18, 0); x18 -= l.x * x0; x18 -= l.y * x1; x18 -= l.z * x2; x18 -= l.w * x3; } { const v4f l = GDN_L4(18, 1); x18 -= l.x * x4; x18 -= l.y * x5; x18 -= l.z * x6; x18 -= l.w * x7; } { const v4f l = GDN_L4(18, 2); x18 -= l.x * x8; x18 -= l.y * x9; x18 -= l.z * x10; x18 -= l.w * x11; } { const v4f l = GDN_L4(18, 3); x18 -= l.x * x12; x18 -= l.y * x13; x18 -= l.z * x14; x18 -= l.w * x15; } { const v4f l = GDN_L4(18, 4); x18 -= l.x * x16; x18 -= l.y * x17; } __builtin_amdgcn_sched_barrier(0);
        float x19 = GDN_RHS(19); { const v4f l = GDN_L4(19, 0); x19 -= l.x * x0; x19 -= l.y * x1; x19 -= l.z * x2; x19 -= l.w * x3; } { const v4f l = GDN_L4(19, 1); x19 -= l.x * x4; x19 -= l.y * x5; x19 -= l.z * x6; x19 -= l.w * x7; } { const v4f l = GDN_L4(19, 2); x19 -= l.x * x8; x19 -= l.y * x9; x19 -= l.z * x10; x19 -= l.w * x11; } { const v4f l = GDN_L4(19, 3); x19 -= l.x * x12; x19 -= l.y * x13; x19 -= l.z * x14; x19 -= l.w * x15; } { const v4f l = GDN_L4(19, 4); x19 -= l.x * x16; x19 -= l.y * x17; x19 -= l.z * x18; } __builtin_amdgcn_sched_barrier(0);
        float x20 = GDN_RHS(20); { const v4f l = GDN_L4(20, 0); x20 -= l.x * x0; x20 -= l.y * x1; x20 -= l.z * x2; x20 -= l.w * x3; } { const v4f l = GDN_L4(20, 1); x20 -= l.x * x4; x20 -= l.y * x5; x20 -= l.z * x6; x20 -= l.w * x7; } { const v4f l = GDN_L4(20, 2); x20 -= l.x * x8; x20 -= l.y * x9; x20 -= l.z * x10; x20 -= l.w * x11; } { const v4f l = GDN_L4(20, 3); x20 -= l.x * x12; x20 -= l.y * x13; x20 -= l.z * x14; x20 -= l.w * x15; } { const v4f l = GDN_L4(20, 4); x20 -= l.x * x16; x20 -= l.y * x17; x20 -= l.z * x18; x20 -= l.w * x19; } __builtin_amdgcn_sched_barrier(0);
        float x21 = GDN_RHS(21); { const v4f l = GDN_L4(21, 0); x21 -= l.x * x0; x21 -= l.y * x1; x21 -= l.z * x2; x21 -= l.w * x3; } { const v4f l = GDN_L4(21, 1); x21 -= l.x * x4; x21 -= l.y * x5; x21 -= l.z * x6; x21 -= l.w * x7; } { const v4f l = GDN_L4(21, 2); x21 -= l.x * x8; x21 -= l.y * x9; x21 -= l.z * x10; x21 -= l.w * x11; } { const v4f l = GDN_L4(21, 3); x21 -= l.x * x12; x21 -= l.y * x13; x21 -= l.z * x14; x21 -= l.w * x15; } { const v4f l = GDN_L4(21, 4); x21 -= l.x * x16; x21 -= l.y * x17; x21 -= l.z * x18; x21 -= l.w * x19; } { const v4f l = GDN_L4(21, 5); x21 -= l.x * x20; } __builtin_amdgcn_sched_barrier(0);
        float x22 = GDN_RHS(22); { const v4f l = GDN_L4(22, 0); x22 -= l.x * x0; x22 -= l.y * x1; x22 -= l.z * x2; x22 -= l.w * x3; } { const v4f l = GDN_L4(22, 1); x22 -= l.x * x4; x22 -= l.y * x5; x22 -= l.z * x6; x22 -= l.w * x7; } { const v4f l = GDN_L4(22, 2); x22 -= l.x * x8; x22 -= l.y * x9; x22 -= l.z * x10; x22 -= l.w * x11; } { const v4f l = GDN_L4(22, 3); x22 -= l.x * x12; x22 -= l.y * x13; x22 -= l.z * x14; x22 -= l.w * x15; } { const v4f l = GDN_L4(22, 4); x22 -= l.x * x16; x22 -= l.y * x17; x22 -= l.z * x18; x22 -= l.w * x19; } { const v4f l = GDN_L4(22, 5); x22 -= l.x * x20; x22 -= l.y * x21; } __builtin_amdgcn_sched_barrier(0);
        float x23 = GDN_RHS(23); { const v4f l = GDN_L4(23, 0); x23 -= l.x * x0; x23 -= l.y * x1; x23 -= l.z * x2; x23 -= l.w * x3; } { const v4f l = GDN_L4(23, 1); x23 -= l.x * x4; x23 -= l.y * x5; x23 -= l.z * x6; x23 -= l.w * x7; } { const v4f l = GDN_L4(23, 2); x23 -= l.x * x8; x23 -= l.y * x9; x23 -= l.z * x10; x23 -= l.w * x11; } { const v4f l = GDN_L4(23, 3); x23 -= l.x * x12; x23 -= l.y * x13; x23 -= l.z * x14; x23 -= l.w * x15; } { const v4f l = GDN_L4(23, 4); x23 -= l.x * x16; x23 -= l.y * x17; x23 -= l.z * x18; x23 -= l.w * x19; } { const v4f l = GDN_L4(23, 5); x23 -= l.x * x20; x23 -= l.y * x21; x23 -= l.z * x22; } __builtin_amdgcn_sched_barrier(0);
        float x24 = GDN_RHS(24); { const v4f l = GDN_L4(24, 0); x24 -= l.x * x0; x24 -= l.y * x1; x24 -= l.z * x2; x24 -= l.w * x3; } { const v4f l = GDN_L4(24, 1); x24 -= l.x * x4; x24 -= l.y * x5; x24 -= l.z * x6; x24 -= l.w * x7; } { const v4f l = GDN_L4(24, 2); x24 -= l.x * x8; x24 -= l.y * x9; x24 -= l.z * x10; x24 -= l.w * x11; } { const v4f l = GDN_L4(24, 3); x24 -= l.x * x12; x24 -= l.y * x13; x24 -= l.z * x14; x24 -= l.w * x15; } { const v4f l = GDN_L4(24, 4); x24 -= l.x * x16; x24 -= l.y * x17; x24 -= l.z * x18; x24 -= l.w * x19; } { const v4f l = GDN_L4(24, 5); x24 -= l.x * x20; x24 -= l.y * x21; x24 -= l.z * x22; x24 -= l.w * x23; } __builtin_amdgcn_sched_barrier(0);
        float x25 = GDN_RHS(25); { const v4f l = GDN_L4(25, 0); x25 -= l.x * x0; x25 -= l.y * x1; x25 -= l.z * x2; x25 -= l.w * x3; } { const v4f l = GDN_L4(25, 1); x25 -= l.x * x4; x25 -= l.y * x5; x25 -= l.z * x6; x25 -= l.w * x7; } { const v4f l = GDN_L4(25, 2); x25 -= l.x * x8; x25 -= l.y * x9; x25 -= l.z * x10; x25 -= l.w * x11; } { const v4f l = GDN_L4(25, 3); x25 -= l.x * x12; x25 -= l.y * x13; x25 -= l.z * x14; x25 -= l.w * x15; } { const v4f l = GDN_L4(25, 4); x25 -= l.x * x16; x25 -= l.y * x17; x25 -= l.z * x18; x25 -= l.w * x19; } { const v4f l = GDN_L4(25, 5); x25 -= l.x * x20; x25 -= l.y * x21; x25 -= l.z * x22; x25 -= l.w * x23; } { const v4f l = GDN_L4(25, 6); x25 -= l.x * x24; } __builtin_amdgcn_sched_barrier(0);
        float x26 = GDN_RHS(26); { const v4f l = GDN_L4(26, 0); x26 -= l.x * x0; x26 -= l.y * x1; x26 -= l.z * x2; x26 -= l.w * x3; } { const v4f l = GDN_L4(26, 1); x26 -= l.x * x4; x26 -= l.y * x5; x26 -= l.z * x6; x26 -= l.w * x7; } { const v4f l = GDN_L4(26, 2); x26 -= l.x * x8; x26 -= l.y * x9; x26 -= l.z * x10; x26 -= l.w * x11; } { const v4f l = GDN_L4(26, 3); x26 -= l.x * x12; x26 -= l.y * x13; x26 -= l.z * x14; x26 -= l.w * x15; } { const v4f l = GDN_L4(26, 4); x26 -= l.x * x16; x26 -= l.y * x17; x26 -= l.z * x18; x26 -= l.w * x19; } { const v4f l = GDN_L4(26, 5); x26 -= l.x * x20; x26 -= l.y * x21; x26 -= l.z * x22; x26 -= l.w * x23; } { const v4f l = GDN_L4(26, 6); x26 -= l.x * x24; x26 -= l.y * x25; } __builtin_amdgcn_sched_barrier(0);
        float x27 = GDN_RHS(27); { const v4f l = GDN_L4(27, 0); x27 -= l.x * x0; x27 -= l.y * x1; x27 -= l.z * x2; x27 -= l.w * x3; } { const v4f l = GDN_L4(27, 1); x27 -= l.x * x4; x27 -= l.y * x5; x27 -= l.z * x6; x27 -= l.w * x7; } { const v4f l = GDN_L4(27, 2); x27 -= l.x * x8; x27 -= l.y * x9; x27 -= l.z * x10; x27 -= l.w * x11; } { const v4f l = GDN_L4(27, 3); x27 -= l.x * x12; x27 -= l.y * x13; x27 -= l.z * x14; x27 -= l.w * x15; } { const v4f l = GDN_L4(27, 4); x27 -= l.x * x16; x27 -= l.y * x17; x27 -= l.z * x18; x27 -= l.w * x19; } { const v4f l = GDN_L4(27, 5); x27 -= l.x * x20; x27 -= l.y * x21; x27 -= l.z * x22; x27 -= l.w * x23; } { const v4f l = GDN_L4(27, 6); x27 -= l.x * x24; x27 -= l.y * x25; x27 -= l.z * x26; } __builtin_amdgcn_sched_barrier(0);
        float x28 = GDN_RHS(28); { const v4f l = GDN_L4(28, 0); x28 -= l.x * x0; x28 -= l.y * x1; x28 -= l.z * x2; x28 -= l.w * x3; } { const v4f l = GDN_L4(28, 1); x28 -= l.x * x4; x28 -= l.y * x5; x28 -= l.z * x6; x28 -= l.w * x7; } { const v4f l = GDN_L4(28, 2); x28 -= l.x * x8; x28 -= l.y * x9; x28 -= l.z * x10; x28 -= l.w * x11; } { const v4f l = GDN_L4(28, 3); x28 -= l.x * x12; x28 -= l.y * x13; x28 -= l.z * x14; x28 -= l.w * x15; } { const v4f l = GDN_L4(28, 4); x28 -= l.x * x16; x28 -= l.y * x17; x28 -= l.z * x18; x28 -= l.w * x19; } { const v4f l = GDN_L4(28, 5); x28 -= l.x * x20; x28 -= l.y * x21; x28 -= l.z * x22; x28 -= l.w * x23; } { const v4f l = GDN_L4(28, 6); x28 -= l.x * x24; x28 -= l.y * x25; x28 -= l.z * x26; x28 -= l.w * x27; } __builtin_amdgcn_sched_barrier(0);
        float x29 = GDN_RHS(29); { const v4f l = GDN_L4(29, 0); x29 -= l.x * x0; x29 -= l.y * x1; x29 -= l.z * x2; x29 -= l.w * x3; } { const v4f l = GDN_L4(29, 1); x29 -= l.x * x4; x29 -= l.y * x5; x29 -= l.z * x6; x29 -= l.w * x7; } { const v4f l = GDN_L4(29, 2); x29 -= l.x * x8; x29 -= l.y * x9; x29 -= l.z * x10; x29 -= l.w * x11; } { const v4f l = GDN_L4(29, 3); x29 -= l.x * x12; x29 -= l.y * x13; x29 -= l.z * x14; x29 -= l.w * x15; } { const v4f l = GDN_L4(29, 4); x29 -= l.x * x16; x29 -= l.y * x17; x29 -= l.z * x18; x29 -= l.w * x19; } { const v4f l = GDN_L4(29, 5); x29 -= l.x * x20; x29 -= l.y * x21; x29 -= l.z * x22; x29 -= l.w * x23; } { const v4f l = GDN_L4(29, 6); x29 -= l.x * x24; x29 -= l.y * x25; x29 -= l.z * x26; x29 -= l.w * x27; } { const v4f l = GDN_L4(29, 7); x29 -= l.x * x28; } __builtin_amdgcn_sched_barrier(0);
        float x30 = GDN_RHS(30); { const v4f l = GDN_L4(30, 0); x30 -= l.x * x0; x30 -= l.y * x1; x30 -= l.z * x2; x30 -= l.w * x3; } { const v4f l = GDN_L4(30, 1); x30 -= l.x * x4; x30 -= l.y * x5; x30 -= l.z * x6; x30 -= l.w * x7; } { const v4f l = GDN_L4(30, 2); x30 -= l.x * x8; x30 -= l.y * x9; x30 -= l.z * x10; x30 -= l.w * x11; } { const v4f l = GDN_L4(30, 3); x30 -= l.x * x12; x30 -= l.y * x13; x30 -= l.z * x14; x30 -= l.w * x15; } { const v4f l = GDN_L4(30, 4); x30 -= l.x * x16; x30 -= l.y * x17; x30 -= l.z * x18; x30 -= l.w * x19; } { const v4f l = GDN_L4(30, 5); x30 -= l.x * x20; x30 -= l.y * x21; x30 -= l.z * x22; x30 -= l.w * x23; } { const v4f l = GDN_L4(30, 6); x30 -= l.x * x24; x30 -= l.y * x25; x30 -= l.z * x26; x30 -= l.w * x27; } { const v4f l = GDN_L4(30, 7); x30 -= l.x * x28; x30 -= l.y * x29; } __builtin_amdgcn_sched_barrier(0);
        float x31 = GDN_RHS(31); { const v4f l = GDN_L4(31, 0); x31 -= l.x * x0; x31 -= l.y * x1; x31 -= l.z * x2; x31 -= l.w * x3; } { const v4f l = GDN_L4(31, 1); x31 -= l.x * x4; x31 -= l.y * x5; x31 -= l.z * x6; x31 -= l.w * x7; } { const v4f l = GDN_L4(31, 2); x31 -= l.x * x8; x31 -= l.y * x9; x31 -= l.z * x10; x31 -= l.w * x11; } { const v4f l = GDN_L4(31, 3); x31 -= l.x * x12; x31 -= l.y * x13; x31 -= l.z * x14; x31 -= l.w * x15; } { const v4f l = GDN_L4(31, 4); x31 -= l.x * x16; x31 -= l.y * x17; x31 -= l.z * x18; x31 -= l.w * x19; } { const v4f l = GDN_L4(31, 5); x31 -= l.x * x20; x31 -= l.y * x21; x31 -= l.z * x22; x31 -= l.w * x23; } { const v4f l = GDN_L4(31, 6); x31 -= l.x * x24; x31 -= l.y * x25; x31 -= l.z * x26; x31 -= l.w * x27; } { const v4f l = GDN_L4(31, 7); x31 -= l.x * x28; x31 -= l.y * x29; x31 -= l.z * x30; } __builtin_amdgcn_sched_barrier(0);
        float x32 = GDN_RHS(32); { const v4f l = GDN_L4(32, 0); x32 -= l.x * x0; x32 -= l.y * x1; x32 -= l.z * x2; x32 -= l.w * x3; } { const v4f l = GDN_L4(32, 1); x32 -= l.x * x4; x32 -= l.y * x5; x32 -= l.z * x6; x32 -= l.w * x7; } { const v4f l = GDN_L4(32, 2); x32 -= l.x * x8; x32 -= l.y * x9; x32 -= l.z * x10; x32 -= l.w * x11; } { const v4f l = GDN_L4(32, 3); x32 -= l.x * x12; x32 -= l.y * x13; x32 -= l.z * x14; x32 -= l.w * x15; } { const v4f l = GDN_L4(32, 4); x32 -= l.x * x16; x32 -= l.y * x17; x32 -= l.z * x18; x32 -= l.w * x19; } { const v4f l = GDN_L4(32, 5); x32 -= l.x * x20; x32 -= l.y * x21; x32 -= l.z * x22; x32 -= l.w * x23; } { const v4f l = GDN_L4(32, 6); x32 -= l.x * x24; x32 -= l.y * x25; x32 -= l.z * x26; x32 -= l.w * x27; } { const v4f l = GDN_L4(32, 7); x32 -= l.x * x28; x32 -= l.y * x29; x32 -= l.z * x30; x32 -= l.w * x31; } __builtin_amdgcn_sched_barrier(0);
        float x33 = GDN_RHS(33); { const v4f l = GDN_L4(33, 0); x33 -= l.x * x0; x33 -= l.y * x1; x33 -= l.z * x2; x33 -= l.w * x3; } { const v4f l = GDN_L4(33, 1); x33 -= l.x * x4; x33 -= l.y * x5; x33 -= l.z * x6; x33 -= l.w * x7; } { const v4f l = GDN_L4(33, 2); x33 -= l.x * x8; x33 -= l.y * x9; x33 -= l.z * x10; x33 -= l.w * x11; } { const v4f l = GDN_L4(33, 3); x33 -= l.x * x12; x33 -= l.y * x13; x33 -= l.z * x14; x33 -= l.w * x15; } { const v4f l = GDN_L4(33, 4); x33 -= l.x * x16; x33 -= l.y * x17; x33 -= l.z * x18; x33 -= l.w * x19; } { const v4f l = GDN_L4(33, 5); x33 -= l.x * x20; x33 -= l.y * x21; x33 -= l.z * x22; x33 -= l.w * x23; } { const v4f l = GDN_L4(33, 6); x33 -= l.x * x24; x33 -= l.y * x25; x33 -= l.z * x26; x33 -= l.w * x27; } { const v4f l = GDN_L4(33, 7); x33 -= l.x * x28; x33 -= l.y * x29; x33 -= l.z * x30; x33 -= l.w * x31; } { const v4f l = GDN_L4(33, 8); x33 -= l.x * x32; } __builtin_amdgcn_sched_barrier(0);
        float x34 = GDN_RHS(34); { const v4f l = GDN_L4(34, 0); x34 -= l.x * x0; x34 -= l.y * x1; x34 -= l.z * x2; x34 -= l.w * x3; } { const v4f l = GDN_L4(34, 1); x34 -= l.x * x4; x34 -= l.y * x5; x34 -= l.z * x6; x34 -= l.w * x7; } { const v4f l = GDN_L4(34, 2); x34 -= l.x * x8; x34 -= l.y * x9; x34 -= l.z * x10; x34 -= l.w * x11; } { const v4f l = GDN_L4(34, 3); x34 -= l.x * x12; x34 -= l.y * x13; x34 -= l.z * x14; x34 -= l.w * x15; } { const v4f l = GDN_L4(34, 4); x34 -= l.x * x16; x34 -= l.y * x17; x34 -= l.z * x18; x34 -= l.w * x19; } { const v4f l = GDN_L4(34, 5); x34 -= l.x * x20; x34 -= l.y * x21; x34 -= l.z * x22; x34 -= l.w * x23; } { const v4f l = GDN_L4(34, 6); x34 -= l.x * x24; x34 -= l.y * x25; x34 -= l.z * x26; x34 -= l.w * x27; } { const v4f l = GDN_L4(34, 7); x34 -= l.x * x28; x34 -= l.y * x29; x34 -= l.z * x30; x34 -= l.w * x31; } { const v4f l = GDN_L4(34, 8); x34 -= l.x * x32; x34 -= l.y * x33; } __builtin_amdgcn_sched_barrier(0);
        float x35 = GDN_RHS(35); { const v4f l = GDN_L4(35, 0); x35 -= l.x * x0; x35 -= l.y * x1; x35 -= l.z * x2; x35 -= l.w * x3; } { const v4f l = GDN_L4(35, 1); x35 -= l.x * x4; x35 -= l.y * x5; x35 -= l.z * x6; x35 -= l.w * x7; } { const v4f l = GDN_L4(35, 2); x35 -= l.x * x8; x35 -= l.y * x9; x35 -= l.z * x10; x35 -= l.w * x11; } { const v4f l = GDN_L4(35, 3); x35 -= l.x * x12; x35 -= l.y * x13; x35 -= l.z * x14; x35 -= l.w * x15; } { const v4f l = GDN_L4(35, 4); x35 -= l.x * x16; x35 -= l.y * x17; x35 -= l.z * x18; x35 -= l.w * x19; } { const v4f l = GDN_L4(35, 5); x35 -= l.x * x20; x35 -= l.y * x21; x35 -= l.z * x22; x35 -= l.w * x23; } { const v4f l = GDN_L4(35, 6); x35 -= l.x * x24; x35 -= l.y * x25; x35 -= l.z * x26; x35 -= l.w * x27; } { const v4f l = GDN_L4(35, 7); x35 -= l.x * x28; x35 -= l.y * x29; x35 -= l.z * x30; x35 -= l.w * x31; } { const v4f l = GDN_L4(35, 8); x35 -= l.x * x32; x35 -= l.y * x33; x35 -= l.z * x34; } __builtin_amdgcn_sched_barrier(0);
        float x36 = GDN_RHS(36); { const v4f l = GDN_L4(36, 0); x36 -= l.x * x0; x36 -= l.y * x1; x36 -= l.z * x2; x36 -= l.w * x3; } { const v4f l = GDN_L4(36, 1); x36 -= l.x * x4; x36 -= l.y * x5; x36 -= l.z * x6; x36 -= l.w * x7; } { const v4f l = GDN_L4(36, 2); x36 -= l.x * x8; x36 -= l.y * x9; x36 -= l.z * x10; x36 -= l.w * x11; } { const v4f l = GDN_L4(36, 3); x36 -= l.x * x12; x36 -= l.y * x13; x36 -= l.z * x14; x36 -= l.w * x15; } { const v4f l = GDN_L4(36, 4); x36 -= l.x * x16; x36 -= l.y * x17; x36 -= l.z * x18; x36 -= l.w * x19; } { const v4f l = GDN_L4(36, 5); x36 -= l.x * x20; x36 -= l.y * x21; x36 -= l.z * x22; x36 -= l.w * x23; } { const v4f l = GDN_L4(36, 6); x36 -= l.x * x24; x36 -= l.y * x25; x36 -= l.z * x26; x36 -= l.w * x27; } { const v4f l = GDN_L4(36, 7); x36 -= l.x * x28; x36 -= l.y * x29; x36 -= l.z * x30; x36 -= l.w * x31; } { const v4f l = GDN_L4(36, 8); x36 -= l.x * x32; x36 -= l.y * x33; x36 -= l.z * x34; x36 -= l.w * x35; } __builtin_amdgcn_sched_barrier(0);
        float x37 = GDN_RHS(37); { const v4f l = GDN_L4(37, 0); x37 -= l.x * x0; x37 -= l.y * x1; x37 -= l.z * x2; x37 -= l.w * x3; } { const v4f l = GDN_L4(37, 1); x37 -= l.x * x4; x37 -= l.y * x5; x37 -= l.z * x6; x37 -= l.w * x7; } { const v4f l = GDN_L4(37, 2); x37 -= l.x * x8; x37 -= l.y * x9; x37 -= l.z * x10; x37 -= l.w * x11; } { const v4f l = GDN_L4(37, 3); x37 -= l.x * x12; x37 -= l.y * x13; x37 -= l.z * x14; x37 -= l.w * x15; } { const v4f l = GDN_L4(37, 4); x37 -= l.x * x16; x37 -= l.y * x17; x37 -= l.z * x18; x37 -= l.w * x19; } { const v4f l = GDN_L4(37, 5); x37 -= l.x * x20; x37 -= l.y * x21; x37 -= l.z * x22; x37 -= l.w * x23; } { const v4f l = GDN_L4(37, 6); x37 -= l.x * x24; x37 -= l.y * x25; x37 -= l.z * x26; x37 -= l.w * x27; } { const v4f l = GDN_L4(37, 7); x37 -= l.x * x28; x37 -= l.y * x29; x37 -= l.z * x30; x37 -= l.w * x31; } { const v4f l = GDN_L4(37, 8); x37 -= l.x * x32; x37 -= l.y * x33; x37 -= l.z * x34; x37 -= l.w * x35; } { const v4f l = GDN_L4(37, 9); x37 -= l.x * x36; } __builtin_amdgcn_sched_barrier(0);
        float x38 = GDN_RHS(38); { const v4f l = GDN_L4(38, 0); x38 -= l.x * x0; x38 -= l.y * x1; x38 -= l.z * x2; x38 -= l.w * x3; } { const v4f l = GDN_L4(38, 1); x38 -= l.x * x4; x38 -= l.y * x5; x38 -= l.z * x6; x38 -= l.w * x7; } { const v4f l = GDN_L4(38, 2); x38 -= l.x * x8; x38 -= l.y * x9; x38 -= l.z * x10; x38 -= l.w * x11; } { const v4f l = GDN_L4(38, 3); x38 -= l.x * x12; x38 -= l.y * x13; x38 -= l.z * x14; x38 -= l.w * x15; } { const v4f l = GDN_L4(38, 4); x38 -= l.x * x16; x38 -= l.y * x17; x38 -= l.z * x18; x38 -= l.w * x19; } { const v4f l = GDN_L4(38, 5); x38 -= l.x * x20; x38 -= l.y * x21; x38 -= l.z * x22; x38 -= l.w * x23; } { const v4f l = GDN_L4(38, 6); x38 -= l.x * x24; x38 -= l.y * x25; x38 -= l.z * x26; x38 -= l.w * x27; } { const v4f l = GDN_L4(38, 7); x38 -= l.x * x28; x38 -= l.y * x29; x38 -= l.z * x30; x38 -= l.w * x31; } { const v4f l = GDN_L4(38, 8); x38 -= l.x * x32; x38 -= l.y * x33; x38 -= l.z * x34; x38 -= l.w * x35; } { const v4f l = GDN_L4(38, 9); x38 -= l.x * x36; x38 -= l.y * x37; } __builtin_amdgcn_sched_barrier(0);
        float x39 = GDN_RHS(39); { const v4f l = GDN_L4(39, 0); x39 -= l.x * x0; x39 -= l.y * x1; x39 -= l.z * x2; x39 -= l.w * x3; } { const v4f l = GDN_L4(39, 1); x39 -= l.x * x4; x39 -= l.y * x5; x39 -= l.z * x6; x39 -= l.w * x7; } { const v4f l = GDN_L4(39, 2); x39 -= l.x * x8; x39 -= l.y * x9; x39 -= l.z * x10; x39 -= l.w * x11; } { const v4f l = GDN_L4(39, 3); x39 -= l.x * x12; x39 -= l.y * x13; x39 -= l.z * x14; x39 -= l.w * x15; } { const v4f l = GDN_L4(39, 4); x39 -= l.x * x16; x39 -= l.y * x17; x39 -= l.z * x18; x39 -= l.w * x19; } { const v4f l = GDN_L4(39, 5); x39 -= l.x * x20; x39 -= l.y * x21; x39 -= l.z * x22; x39 -= l.w * x23; } { const v4f l = GDN_L4(39, 6); x39 -= l.x * x24; x39 -= l.y * x25; x39 -= l.z * x26; x39 -= l.w * x27; } { const v4f l = GDN_L4(39, 7); x39 -= l.x * x28; x39 -= l.y * x29; x39 -= l.z * x30; x39 -= l.w * x31; } { const v4f l = GDN_L4(39, 8); x39 -= l.x * x32; x39 -= l.y * x33; x39 -= l.z * x34; x39 -= l.w * x35; } { const v4f l = GDN_L4(39, 9); x39 -= l.x * x36; x39 -= l.y * x37; x39 -= l.z * x38; } __builtin_amdgcn_sched_barrier(0);
        float x40 = GDN_RHS(40); { const v4f l = GDN_L4(40, 0); x40 -= l.x * x0; x40 -= l.y * x1; x40 -= l.z * x2; x40 -= l.w * x3; } { const v4f l = GDN_L4(40, 1); x40 -= l.x * x4; x40 -= l.y * x5; x40 -= l.z * x6; x40 -= l.w * x7; } { const v4f l = GDN_L4(40, 2); x40 -= l.x * x8; x40 -= l.y * x9; x40 -= l.z * x10; x40 -= l.w * x11; } { const v4f l = GDN_L4(40, 3); x40 -= l.x * x12; x40 -= l.y * x13; x40 -= l.z * x14; x40 -= l.w * x15; } { const v4f l = GDN_L4(40, 4); x40 -= l.x * x16; x40 -= l.y * x17; x40 -= l.z * x18; x40 -= l.w * x19; } { const v4f l = GDN_L4(40, 5); x40 -= l.x * x20; x40 -= l.y * x21; x40 -= l.z * x22; x40 -= l.w * x23; } { const v4f l = GDN_L4(40, 6); x40 -= l.x * x24; x40 -= l.y * x25; x40 -= l.z * x26; x40 -= l.w * x27; } { const v4f l = GDN_L4(40, 7); x40 -= l.x * x28; x40 -= l.y * x29; x40 -= l.z * x30; x40 -= l.w * x31; } { const v4f l = GDN_L4(40, 8); x40 -= l.x * x32; x40 -= l.y * x33; x40 -= l.z * x34; x40 -= l.w * x35; } { const v4f l = GDN_L4(40, 9); x40 -= l.x * x36; x40 -= l.y * x37; x40 -= l.z * x38; x40 -= l.w * x39; } __builtin_amdgcn_sched_barrier(0);
        float x41 = GDN_RHS(41); { const v4f l = GDN_L4(41, 0); x41 -= l.x * x0; x41 -= l.y * x1; x41 -= l.z * x2; x41 -= l.w * x3; } { const v4f l = GDN_L4(41, 1); x41 -= l.x * x4; x41 -= l.y * x5; x41 -= l.z * x6; x41 -= l.w * x7; } { const v4f l = GDN_L4(41, 2); x41 -= l.x * x8; x41 -= l.y * x9; x41 -= l.z * x10; x41 -= l.w * x11; } { const v4f l = GDN_L4(41, 3); x41 -= l.x * x12; x41 -= l.y * x13; x41 -= l.z * x14; x41 -= l.w * x15; } { const v4f l = GDN_L4(41, 4); x41 -= l.x * x16; x41 -= l.y * x17; x41 -= l.z * x18; x41 -= l.w * x19; } { const v4f l = GDN_L4(41, 5); x41 -= l.x * x20; x41 -= l.y * x21; x41 -= l.z * x22; x41 -= l.w * x23; } { const v4f l = GDN_L4(41, 6); x41 -= l.x * x24; x41 -= l.y * x25; x41 -= l.z * x26; x41 -= l.w * x27; } { const v4f l = GDN_L4(41, 7); x41 -= l.x * x28; x41 -= l.y * x29; x41 -= l.z * x30; x41 -= l.w * x31; } { const v4f l = GDN_L4(41, 8); x41 -= l.x * x32; x41 -= l.y * x33; x41 -= l.z * x34; x41 -= l.w * x35; } { const v4f l = GDN_L4(41, 9); x41 -= l.x * x36; x41 -= l.y * x37; x41 -= l.z * x38; x41 -= l.w * x39; } { const v4f l = GDN_L4(41, 10); x41 -= l.x * x40; } __builtin_amdgcn_sched_barrier(0);
        float x42 = GDN_RHS(42); { const v4f l = GDN_L4(42, 0); x42 -= l.x * x0; x42 -= l.y * x1; x42 -= l.z * x2; x42 -= l.w * x3; } { const v4f l = GDN_L4(42, 1); x42 -= l.x * x4; x42 -= l.y * x5; x42 -= l.z * x6; x42 -= l.w * x7; } { const v4f l = GDN_L4(42, 2); x42 -= l.x * x8; x42 -= l.y * x9; x42 -= l.z * x10; x42 -= l.w * x11; } { const v4f l = GDN_L4(42, 3); x42 -= l.x * x12; x42 -= l.y * x13; x42 -= l.z * x14; x42 -= l.w * x15; } { const v4f l = GDN_L4(42, 4); x42 -= l.x * x16; x42 -= l.y * x17; x42 -= l.z * x18; x42 -= l.w * x19; } { const v4f l = GDN_L4(42, 5); x42 -= l.x * x20; x42 -= l.y * x21; x42 -= l.z * x22; x42 -= l.w * x23; } { const v4f l = GDN_L4(42, 6); x42 -= l.x * x24; x42 -= l.y * x25; x42 -= l.z * x26; x42 -= l.w * x27; } { const v4f l = GDN_L4(42, 7); x42 -= l.x * x28; x42 -= l.y * x29; x42 -= l.z * x30; x42 -= l.w * x31; } { const v4f l = GDN_L4(42, 8); x42 -= l.x * x32; x42 -= l.y * x33; x42 -= l.z * x34; x42 -= l.w * x35; } { const v4f l = GDN_L4(42, 9); x42 -= l.x * x36; x42 -= l.y * x37; x42 -= l.z * x38; x42 -= l.w * x39; } { const v4f l = GDN_L4(42, 10); x42 -= l.x * x40; x42 -= l.y * x41; } __builtin_amdgcn_sched_barrier(0);
        float x43 = GDN_RHS(43); { const v4f l = GDN_L4(43, 0); x43 -= l.x * x0; x43 -= l.y * x1; x43 -= l.z * x2; x43 -= l.w * x3; } { const v4f l = GDN_L4(43, 1); x43 -= l.x * x4; x43 -= l.y * x5; x43 -= l.z * x6; x43 -= l.w * x7; } { const v4f l = GDN_L4(43, 2); x43 -= l.x * x8; x43 -= l.y * x9; x43 -= l.z * x10; x43 -= l.w * x11; } { const v4f l = GDN_L4(43, 3); x43 -= l.x * x12; x43 -= l.y * x13; x43 -= l.z * x14; x43 -= l.w * x15; } { const v4f l = GDN_L4(43, 4); x43 -= l.x * x16; x43 -= l.y * x17; x43 -= l.z * x18; x43 -= l.w * x19; } { const v4f l = GDN_L4(43, 5); x43 -= l.x * x20; x43 -= l.y * x21; x43 -= l.z * x22; x43 -= l.w * x23; } { const v4f l = GDN_L4(43, 6); x43 -= l.x * x24; x43 -= l.y * x25; x43 -= l.z * x26; x43 -= l.w * x27; } { const v4f l = GDN_L4(43, 7); x43 -= l.x * x28; x43 -= l.y * x29; x43 -= l.z * x30; x43 -= l.w * x31; } { const v4f l = GDN_L4(43, 8); x43 -= l.x * x32; x43 -= l.y * x33; x43 -= l.z * x34; x43 -= l.w * x35; } { const v4f l = GDN_L4(43, 9); x43 -= l.x * x36; x43 -= l.y * x37; x43 -= l.z * x38; x43 -= l.w * x39; } { const v4f l = GDN_L4(43, 10); x43 -= l.x * x40; x43 -= l.y * x41; x43 -= l.z * x42; } __builtin_amdgcn_sched_barrier(0);
        float x44 = GDN_RHS(44); { const v4f l = GDN_L4(44, 0); x44 -= l.x * x0; x44 -= l.y * x1; x44 -= l.z * x2; x44 -= l.w * x3; } { const v4f l = GDN_L4(44, 1); x44 -= l.x * x4; x44 -= l.y * x5; x44 -= l.z * x6; x44 -= l.w * x7; } { const v4f l = GDN_L4(44, 2); x44 -= l.x * x8; x44 -= l.y * x9; x44 -= l.z * x10; x44 -= l.w * x11; } { const v4f l = GDN_L4(44, 3); x44 -= l.x * x12; x44 -= l.y * x13; x44 -= l.z * x14; x44 -= l.w * x15; } { const v4f l = GDN_L4(44, 4); x44 -= l.x * x16; x44 -= l.y * x17; x44 -= l.z * x18; x44 -= l.w * x19; } { const v4f l = GDN_L4(44, 5); x44 -= l.x * x20; x44 -= l.y * x21; x44 -= l.z * x22; x44 -= l.w * x23; } { const v4f l = GDN_L4(44, 6); x44 -= l.x * x24; x44 -= l.y * x25; x44 -= l.z * x26; x44 -= l.w * x27; } { const v4f l = GDN_L4(44, 7); x44 -= l.x * x28; x44 -= l.y * x29; x44 -= l.z * x30; x44 -= l.w * x31; } { const v4f l = GDN_L4(44, 8); x44 -= l.x * x32; x44 -= l.y * x33; x44 -= l.z * x34; x44 -= l.w * x35; } { const v4f l = GDN_L4(44, 9); x44 -= l.x * x36; x44 -= l.y * x37; x44 -= l.z * x38; x44 -= l.w * x39; } { const v4f l = GDN_L4(44, 10); x44 -= l.x * x40; x44 -= l.y * x41; x44 -= l.z * x42; x44 -= l.w * x43; } __builtin_amdgcn_sched_barrier(0);
        float x45 = GDN_RHS(45); { const v4f l = GDN_L4(45, 0); x45 -= l.x * x0; x45 -= l.y * x1; x45 -= l.z * x2; x45 -= l.w * x3; } { const v4f l = GDN_L4(45, 1); x45 -= l.x * x4; x45 -= l.y * x5; x45 -= l.z * x6; x45 -= l.w * x7; } { const v4f l = GDN_L4(45, 2); x45 -= l.x * x8; x45 -= l.y * x9; x45 -= l.z * x10; x45 -= l.w * x11; } { const v4f l = GDN_L4(45, 3); x45 -= l.x * x12; x45 -= l.y * x13; x45 -= l.z * x14; x45 -= l.w * x15; } { const v4f l = GDN_L4(45, 4); x45 -= l.x * x16; x45 -= l.y * x17; x45 -= l.z * x18; x45 -= l.w * x19; } { const v4f l = GDN_L4(45, 5); x45 -= l.x * x20; x45 -= l.y * x21; x45 -= l.z * x22; x45 -= l.w * x23; } { const v4f l = GDN_L4(45, 6); x45 -= l.x * x24; x45 -= l.y * x25; x45 -= l.z * x26; x45 -= l.w * x27; } { const v4f l = GDN_L4(45, 7); x45 -= l.x * x28; x45 -= l.y * x29; x45 -= l.z * x30; x45 -= l.w * x31; } { const v4f l = GDN_L4(45, 8); x45 -= l.x * x32; x45 -= l.y * x33; x45 -= l.z * x34; x45 -= l.w * x35; } { const v4f l = GDN_L4(45, 9); x45 -= l.x * x36; x45 -= l.y * x37; x45 -= l.z * x38; x45 -= l.w * x39; } { const v4f l = GDN_L4(45, 10); x45 -= l.x * x40; x45 -= l.y * x41; x45 -= l.z * x42; x45 -= l.w * x43; } { const v4f l = GDN_L4(45, 11); x45 -= l.x * x44; } __builtin_amdgcn_sched_barrier(0);
        float x46 = GDN_RHS(46); { const v4f l = GDN_L4(46, 0); x46 -= l.x * x0; x46 -= l.y * x1; x46 -= l.z * x2; x46 -= l.w * x3; } { const v4f l = GDN_L4(46, 1); x46 -= l.x * x4; x46 -= l.y * x5; x46 -= l.z * x6; x46 -= l.w * x7; } { const v4f l = GDN_L4(46, 2); x46 -= l.x * x8; x46 -= l.y * x9; x46 -= l.z * x10; x46 -= l.w * x11; } { const v4f l = GDN_L4(46, 3); x46 -= l.x * x12; x46 -= l.y * x13; x46 -= l.z * x14; x46 -= l.w * x15; } { const v4f l = GDN_L4(46, 4); x46 -= l.x * x16; x46 -= l.y * x17; x46 -= l.z * x18; x46 -= l.w * x19; } { const v4f l = GDN_L4(46, 5); x46 -= l.x * x20; x46 -= l.y * x21; x46 -= l.z * x22; x46 -= l.w * x23; } { const v4f l = GDN_L4(46, 6); x46 -= l.x * x24; x46 -= l.y * x25; x46 -= l.z * x26; x46 -= l.w * x27; } { const v4f l = GDN_L4(46, 7); x46 -= l.x * x28; x46 -= l.y * x29; x46 -= l.z * x30; x46 -= l.w * x31; } { const v4f l = GDN_L4(46, 8); x46 -= l.x * x32; x46 -= l.y * x33; x46 -= l.z * x34; x46 -= l.w * x35; } { const v4f l = GDN_L4(46, 9); x46 -= l.x * x36; x46 -= l.y * x37; x46 -= l.z * x38; x46 -= l.w * x39; } { const v4f l = GDN_L4(46, 10); x46 -= l.x * x40; x46 -= l.y * x41; x46 -= l.z * x42; x46 -= l.w * x43; } { const v4f l = GDN_L4(46, 11); x46 -= l.x * x44; x46 -= l.y * x45; } __builtin_amdgcn_sched_barrier(0);
        float x47 = GDN_RHS(47); { const v4f l = GDN_L4(47, 0); x47 -= l.x * x0; x47 -= l.y * x1; x47 -= l.z * x2; x47 -= l.w * x3; } { const v4f l = GDN_L4(47, 1); x47 -= l.x * x4; x47 -= l.y * x5; x47 -= l.z * x6; x47 -= l.w * x7; } { const v4f l = GDN_L4(47, 2); x47 -= l.x * x8; x47 -= l.y * x9; x47 -= l.z * x10; x47 -= l.w * x11; } { const v4f l = GDN_L4(47, 3); x47 -= l.x * x12; x47 -= l.y * x13; x47 -= l.z * x14; x47 -= l.w * x15; } { const v4f l = GDN_L4(47, 4); x47 -= l.x * x16; x47 -= l.y * x17; x47 -= l.z * x18; x47 -= l.w * x19; } { const v4f l = GDN_L4(47, 5); x47 -= l.x * x20; x47 -= l.y * x21; x47 -= l.z * x22; x47 -= l.w * x23; } { const v4f l = GDN_L4(47, 6); x47 -= l.x * x24; x47 -= l.y * x25; x47 -= l.z * x26; x47 -= l.w * x27; } { const v4f l = GDN_L4(47, 7); x47 -= l.x * x28; x47 -= l.y * x29; x47 -= l.z * x30; x47 -= l.w * x31; } { const v4f l = GDN_L4(47, 8); x47 -= l.x * x32; x47 -= l.y * x33; x47 -= l.z * x34; x47 -= l.w * x35; } { const v4f l = GDN_L4(47, 9); x47 -= l.x * x36; x47 -= l.y * x37; x47 -= l.z * x38; x47 -= l.w * x39; } { const v4f l = GDN_L4(47, 10); x47 -= l.x * x40; x47 -= l.y * x41; x47 -= l.z * x42; x47 -= l.w * x43; } { const v4f l = GDN_L4(47, 11); x47 -= l.x * x44; x47 -= l.y * x45; x47 -= l.z * x46; } __builtin_amdgcn_sched_barrier(0);
        float x48 = GDN_RHS(48); { const v4f l = GDN_L4(48, 0); x48 -= l.x * x0; x48 -= l.y * x1; x48 -= l.z * x2; x48 -= l.w * x3; } { const v4f l = GDN_L4(48, 1); x48 -= l.x * x4; x48 -= l.y * x5; x48 -= l.z * x6; x48 -= l.w * x7; } { const v4f l = GDN_L4(48, 2); x48 -= l.x * x8; x48 -= l.y * x9; x48 -= l.z * x10; x48 -= l.w * x11; } { const v4f l = GDN_L4(48, 3); x48 -= l.x * x12; x48 -= l.y * x13; x48 -= l.z * x14; x48 -= l.w * x15; } { const v4f l = GDN_L4(48, 4); x48 -= l.x * x16; x48 -= l.y * x17; x48 -= l.z * x18; x48 -= l.w * x19; } { const v4f l = GDN_L4(48, 5); x48 -= l.x * x20; x48 -= l.y * x21; x48 -= l.z * x22; x48 -= l.w * x23; } { const v4f l = GDN_L4(48, 6); x48 -= l.x * x24; x48 -= l.y * x25; x48 -= l.z * x26; x48 -= l.w * x27; } { const v4f l = GDN_L4(48, 7); x48 -= l.x * x28; x48 -= l.y * x29; x48 -= l.z * x30; x48 -= l.w * x31; } { const v4f l = GDN_L4(48, 8); x48 -= l.x * x32; x48 -= l.y * x33; x48 -= l.z * x34; x48 -= l.w * x35; } { const v4f l = GDN_L4(48, 9); x48 -= l.x * x36; x48 -= l.y * x37; x48 -= l.z * x38; x48 -= l.w * x39; } { const v4f l = GDN_L4(48, 10); x48 -= l.x * x40; x48 -= l.y * x41; x48 -= l.z * x42; x48 -= l.w * x43; } { const v4f l = GDN_L4(48, 11); x48 -= l.x * x44; x48 -= l.y * x45; x48 -= l.z * x46; x48 -= l.w * x47; } __builtin_amdgcn_sched_barrier(0);
        float x49 = GDN_RHS(49); { const v4f l = GDN_L4(49, 0); x49 -= l.x * x0; x49 -= l.y * x1; x49 -= l.z * x2; x49 -= l.w * x3; } { const v4f l = GDN_L4(49, 1); x49 -= l.x * x4; x49 -= l.y * x5; x49 -= l.z * x6; x49 -= l.w * x7; } { const v4f l = GDN_L4(49, 2); x49 -= l.x * x8; x49 -= l.y * x9; x49 -= l.z * x10; x49 -= l.w * x11; } { const v4f l = GDN_L4(49, 3); x49 -= l.x * x12; x49 -= l.y * x13; x49 -= l.z * x14; x49 -= l.w * x15; } { const v4f l = GDN_L4(49, 4); x49 -= l.x * x16; x49 -= l.y * x17; x49 -= l.z * x18; x49 -= l.w * x19; } { const v4f l = GDN_L4(49, 5); x49 -= l.x * x20; x49 -= l.y * x21; x49 -= l.z * x22; x49 -= l.w * x23; } { const v4f l = GDN_L4(49, 6); x49 -= l.x * x24; x49 -= l.y * x25; x49 -= l.z * x26; x49 -= l.w * x27; } { const v4f l = GDN_L4(49, 7); x49 -= l.x * x28; x49 -= l.y * x29; x49 -= l.z * x30; x49 -= l.w * x31; } { const v4f l = GDN_L4(49, 8); x49 -= l.x * x32; x49 -= l.y * x33; x49 -= l.z * x34; x49 -= l.w * x35; } { const v4f l = GDN_L4(49, 9); x49 -= l.x * x36; x49 -= l.y * x37; x49 -= l.z * x38; x49 -= l.w * x39; } { const v4f l = GDN_L4(49, 10); x49 -= l.x * x40; x49 -= l.y * x41; x49 -= l.z * x42; x49 -= l.w * x43; } { const v4f l = GDN_L4(49, 11); x49 -= l.x * x44; x49 -= l.y * x45; x49 -= l.z * x46; x49 -= l.w * x47; } { const v4f l = GDN_L4(49, 12); x49 -= l.x * x48; } __builtin_amdgcn_sched_barrier(0);
        float x50 = GDN_RHS(50); { const v4f l = GDN_L4(50, 0); x50 -= l.x * x0; x50 -= l.y * x1; x50 -= l.z * x2; x50 -= l.w * x3; } { const v4f l = GDN_L4(50, 1); x50 -= l.x * x4; x50 -= l.y * x5; x50 -= l.z * x6; x50 -= l.w * x7; } { const v4f l = GDN_L4(50, 2); x50 -= l.x * x8; x50 -= l.y * x9; x50 -= l.z * x10; x50 -= l.w * x11; } { const v4f l = GDN_L4(50, 3); x50 -= l.x * x12; x50 -= l.y * x13; x50 -= l.z * x14; x50 -= l.w * x15; } { const v4f l = GDN_L4(50, 4); x50 -= l.x * x16; x50 -= l.y * x17; x50 -= l.z * x18; x50 -= l.w * x19; } { const v4f l = GDN_L4(50, 5); x50 -= l.x * x20; x50 -= l.y * x21; x50 -= l.z * x22; x50 -= l.w * x23; } { const v4f l = GDN_L4(50, 6); x50 -= l.x * x24; x50 -= l.y * x25; x50 -= l.z * x26; x50 -= l.w * x27; } { const v4f l = GDN_L4(50, 7); x50 -= l.x * x28; x50 -= l.y * x29; x50 -= l.z * x30; x50 -= l.w * x31; } { const v4f l = GDN_L4(50, 8); x50 -= l.x * x32; x50 -= l.y * x33; x50 -= l.z * x34; x50 -= l.w * x35; } { const v4f l = GDN_L4(50, 9); x50 -= l.x * x36; x50 -= l.y * x37; x50 -= l.z * x38; x50 -= l.w * x39; } { const v4f l = GDN_L4(50, 10); x50 -= l.x * x40; x50 -= l.y * x41; x50 -= l.z * x42; x50 -= l.w * x43; } { const v4f l = GDN_L4(50, 11); x50 -= l.x * x44; x50 -= l.y * x45; x50 -= l.z * x46; x50 -= l.w * x47; } { const v4f l = GDN_L4(50, 12); x50 -= l.x * x48; x50 -= l.y * x49; } __builtin_amdgcn_sched_barrier(0);
        float x51 = GDN_RHS(51); { const v4f l = GDN_L4(51, 0); x51 -= l.x * x0; x51 -= l.y * x1; x51 -= l.z * x2; x51 -= l.w * x3; } { const v4f l = GDN_L4(51, 1); x51 -= l.x * x4; x51 -= l.y * x5; x51 -= l.z * x6; x51 -= l.w * x7; } { const v4f l = GDN_L4(51, 2); x51 -= l.x * x8; x51 -= l.y * x9; x51 -= l.z * x10; x51 -= l.w * x11; } { const v4f l = GDN_L4(51, 3); x51 -= l.x * x12; x51 -= l.y * x13; x51 -= l.z * x14; x51 -= l.w * x15; } { const v4f l = GDN_L4(51, 4); x51 -= l.x * x16; x51 -= l.y * x17; x51 -= l.z * x18; x51 -= l.w * x19; } { const v4f l = GDN_L4(51, 5); x51 -= l.x * x20; x51 -= l.y * x21; x51 -= l.z * x22; x51 -= l.w * x23; } { const v4f l = GDN_L4(51, 6); x51 -= l.x * x24; x51 -= l.y * x25; x51 -= l.z * x26; x51 -= l.w * x27; } { const v4f l = GDN_L4(51, 7); x51 -= l.x * x28; x51 -= l.y * x29; x51 -= l.z * x30; x51 -= l.w * x31; } { const v4f l = GDN_L4(51, 8); x51 -= l.x * x32; x51 -= l.y * x33; x51 -= l.z * x34; x51 -= l.w * x35; } { const v4f l = GDN_L4(51, 9); x51 -= l.x * x36; x51 -= l.y * x37; x51 -= l.z * x38; x51 -= l.w * x39; } { const v4f l = GDN_L4(51, 10); x51 -= l.x * x40; x51 -= l.y * x41; x51 -= l.z * x42; x51 -= l.w * x43; } { const v4f l = GDN_L4(51, 11); x51 -= l.x * x44; x51 -= l.y * x45; x51 -= l.z * x46; x51 -= l.w * x47; } { const v4f l = GDN_L4(51, 12); x51 -= l.x * x48; x51 -= l.y * x49; x51 -= l.z * x50; } __builtin_amdgcn_sched_barrier(0);
        float x52 = GDN_RHS(52); { const v4f l = GDN_L4(52, 0); x52 -= l.x * x0; x52 -= l.y * x1; x52 -= l.z * x2; x52 -= l.w * x3; } { const v4f l = GDN_L4(52, 1); x52 -= l.x * x4; x52 -= l.y * x5; x52 -= l.z * x6; x52 -= l.w * x7; } { const v4f l = GDN_L4(52, 2); x52 -= l.x * x8; x52 -= l.y * x9; x52 -= l.z * x10; x52 -= l.w * x11; } { const v4f l = GDN_L4(52, 3); x52 -= l.x * x12; x52 -= l.y * x13; x52 -= l.z * x14; x52 -= l.w * x15; } { const v4f l = GDN_L4(52, 4); x52 -= l.x * x16; x52 -= l.y * x17; x52 -= l.z * x18; x52 -= l.w * x19; } { const v4f l = GDN_L4(52, 5); x52 -= l.x * x20; x52 -= l.y * x21; x52 -= l.z * x22; x52 -= l.w * x23; } { const v4f l = GDN_L4(52, 6); x52 -= l.x * x24; x52 -= l.y * x25; x52 -= l.z * x26; x52 -= l.w * x27; } { const v4f l = GDN_L4(52, 7); x52 -= l.x * x28; x52 -= l.y * x29; x52 -= l.z * x30; x52 -= l.w * x31; } { const v4f l = GDN_L4(52, 8); x52 -= l.x * x32; x52 -= l.y * x33; x52 -= l.z * x34; x52 -= l.w * x35; } { const v4f l = GDN_L4(52, 9); x52 -= l.x * x36; x52 -= l.y * x37; x52 -= l.z * x38; x52 -= l.w * x39; } { const v4f l = GDN_L4(52, 10); x52 -= l.x * x40; x52 -= l.y * x41; x52 -= l.z * x42; x52 -= l.w * x43; } { const v4f l = GDN_L4(52, 11); x52 -= l.x * x44; x52 -= l.y * x45; x52 -= l.z * x46; x52 -= l.w * x47; } { const v4f l = GDN_L4(52, 12); x52 -= l.x * x48; x52 -= l.y * x49; x52 -= l.z * x50; x52 -= l.w * x51; } __builtin_amdgcn_sched_barrier(0);
        float x53 = GDN_RHS(53); { const v4f l = GDN_L4(53, 0); x53 -= l.x * x0; x53 -= l.y * x1; x53 -= l.z * x2; x53 -= l.w * x3; } { const v4f l = GDN_L4(53, 1); x53 -= l.x * x4; x53 -= l.y * x5; x53 -= l.z * x6; x53 -= l.w * x7; } { const v4f l = GDN_L4(53, 2); x53 -= l.x * x8; x53 -= l.y * x9; x53 -= l.z * x10; x53 -= l.w * x11; } { const v4f l = GDN_L4(53, 3); x53 -= l.x * x12; x53 -= l.y * x13; x53 -= l.z * x14; x53 -= l.w * x15; } { const v4f l = GDN_L4(53, 4); x53 -= l.x * x16; x53 -= l.y * x17; x53 -= l.z * x18; x53 -= l.w * x19; } { const v4f l = GDN_L4(53, 5); x53 -= l.x * x20; x53 -= l.y * x21; x53 -= l.z * x22; x53 -= l.w * x23; } { const v4f l = GDN_L4(53, 6); x53 -= l.x * x24; x53 -= l.y * x25; x53 -= l.z * x26; x53 -= l.w * x27; } { const v4f l = GDN_L4(53, 7); x53 -= l.x * x28; x53 -= l.y * x29; x53 -= l.z * x30; x53 -= l.w * x31; } { const v4f l = GDN_L4(53, 8); x53 -= l.x * x32; x53 -= l.y * x33; x53 -= l.z * x34; x53 -= l.w * x35; } { const v4f l = GDN_L4(53, 9); x53 -= l.x * x36; x53 -= l.y * x37; x53 -= l.z * x38; x53 -= l.w * x39; } { const v4f l = GDN_L4(53, 10); x53 -= l.x * x40; x53 -= l.y * x41; x53 -= l.z * x42; x53 -= l.w * x43; } { const v4f l = GDN_L4(53, 11); x53 -= l.x * x44; x53 -= l.y * x45; x53 -= l.z * x46; x53 -= l.w * x47; } { const v4f l = GDN_L4(53, 12); x53 -= l.x * x48; x53 -= l.y * x49; x53 -= l.z * x50; x53 -= l.w * x51; } { const v4f l = GDN_L4(53, 13); x53 -= l.x * x52; } __builtin_amdgcn_sched_barrier(0);
        float x54 = GDN_RHS(54); { const v4f l = GDN_L4(54, 0); x54 -= l.x * x0; x54 -= l.y * x1; x54 -= l.z * x2; x54 -= l.w * x3; } { const v4f l = GDN_L4(54, 1); x54 -= l.x * x4; x54 -= l.y * x5; x54 -= l.z * x6; x54 -= l.w * x7; } { const v4f l = GDN_L4(54, 2); x54 -= l.x * x8; x54 -= l.y * x9; x54 -= l.z * x10; x54 -= l.w * x11; } { const v4f l = GDN_L4(54, 3); x54 -= l.x * x12; x54 -= l.y * x13; x54 -= l.z * x14; x54 -= l.w * x15; } { const v4f l = GDN_L4(54, 4); x54 -= l.x * x16; x54 -= l.y * x17; x54 -= l.z * x18; x54 -= l.w * x19; } { const v4f l = GDN_L4(54, 5); x54 -= l.x * x20; x54 -= l.y * x21; x54 -= l.z * x22; x54 -= l.w * x23; } { const v4f l = GDN_L4(54, 6); x54 -= l.x * x24; x54 -= l.y * x25; x54 -= l.z * x26; x54 -= l.w * x27; } { const v4f l = GDN_L4(54, 7); x54 -= l.x * x28; x54 -= l.y * x29; x54 -= l.z * x30; x54 -= l.w * x31; } { const v4f l = GDN_L4(54, 8); x54 -= l.x * x32; x54 -= l.y * x33; x54 -= l.z * x34; x54 -= l.w * x35; } { const v4f l = GDN_L4(54, 9); x54 -= l.x * x36; x54 -= l.y * x37; x54 -= l.z * x38; x54 -= l.w * x39; } { const v4f l = GDN_L4(54, 10); x54 -= l.x * x40; x54 -= l.y * x41; x54 -= l.z * x42; x54 -= l.w * x43; } { const v4f l = GDN_L4(54, 11); x54 -= l.x * x44; x54 -= l.y * x45; x54 -= l.z * x46; x54 -= l.w * x47; } { const v4f l = GDN_L4(54, 12); x54 -= l.x * x48; x54 -= l.y * x49; x54 -= l.z * x50; x54 -= l.w * x51; } { const v4f l = GDN_L4(54, 13); x54 -= l.x * x52; x54 -= l.y * x53; } __builtin_amdgcn_sched_barrier(0);
        float x55 = GDN_RHS(55); { const v4f l = GDN_L4(55, 0); x55 -= l.x * x0; x55 -= l.y * x1; x55 -= l.z * x2; x55 -= l.w * x3; } { const v4f l = GDN_L4(55, 1); x55 -= l.x * x4; x55 -= l.y * x5; x55 -= l.z * x6; x55 -= l.w * x7; } { const v4f l = GDN_L4(55, 2); x55 -= l.x * x8; x55 -= l.y * x9; x55 -= l.z * x10; x55 -= l.w * x11; } { const v4f l = GDN_L4(55, 3); x55 -= l.x * x12; x55 -= l.y * x13; x55 -= l.z * x14; x55 -= l.w * x15; } { const v4f l = GDN_L4(55, 4); x55 -= l.x * x16; x55 -= l.y * x17; x55 -= l.z * x18; x55 -= l.w * x19; } { const v4f l = GDN_L4(55, 5); x55 -= l.x * x20; x55 -= l.y * x21; x55 -= l.z * x22; x55 -= l.w * x23; } { const v4f l = GDN_L4(55, 6); x55 -= l.x * x24; x55 -= l.y * x25; x55 -= l.z * x26; x55 -= l.w * x27; } { const v4f l = GDN_L4(55, 7); x55 -= l.x * x28; x55 -= l.y * x29; x55 -= l.z * x30; x55 -= l.w * x31; } { const v4f l = GDN_L4(55, 8); x55 -= l.x * x32; x55 -= l.y * x33; x55 -= l.z * x34; x55 -= l.w * x35; } { const v4f l = GDN_L4(55, 9); x55 -= l.x * x36; x55 -= l.y * x37; x55 -= l.z * x38; x55 -= l.w * x39; } { const v4f l = GDN_L4(55, 10); x55 -= l.x * x40; x55 -= l.y * x41; x55 -= l.z * x42; x55 -= l.w * x43; } { const v4f l = GDN_L4(55, 11); x55 -= l.x * x44; x55 -= l.y * x45; x55 -= l.z * x46; x55 -= l.w * x47; } { const v4f l = GDN_L4(55, 12); x55 -= l.x * x48; x55 -= l.y * x49; x55 -= l.z * x50; x55 -= l.w * x51; } { const v4f l = GDN_L4(55, 13); x55 -= l.x * x52; x55 -= l.y * x53; x55 -= l.z * x54; } __builtin_amdgcn_sched_barrier(0);
        float x56 = GDN_RHS(56); { const v4f l = GDN_L4(56, 0); x56 -= l.x * x0; x56 -= l.y * x1; x56 -= l.z * x2; x56 -= l.w * x3; } { const v4f l = GDN_L4(56, 1); x56 -= l.x * x4; x56 -= l.y * x5; x56 -= l.z * x6; x56 -= l.w * x7; } { const v4f l = GDN_L4(56, 2); x56 -= l.x * x8; x56 -= l.y * x9; x56 -= l.z * x10; x56 -= l.w * x11; } { const v4f l = GDN_L4(56, 3); x56 -= l.x * x12; x56 -= l.y * x13; x56 -= l.z * x14; x56 -= l.w * x15; } { const v4f l = GDN_L4(56, 4); x56 -= l.x * x16; x56 -= l.y * x17; x56 -= l.z * x18; x56 -= l.w * x19; } { const v4f l = GDN_L4(56, 5); x56 -= l.x * x20; x56 -= l.y * x21; x56 -= l.z * x22; x56 -= l.w * x23; } { const v4f l = GDN_L4(56, 6); x56 -= l.x * x24; x56 -= l.y * x25; x56 -= l.z * x26; x56 -= l.w * x27; } { const v4f l = GDN_L4(56, 7); x56 -= l.x * x28; x56 -= l.y * x29; x56 -= l.z * x30; x56 -= l.w * x31; } { const v4f l = GDN_L4(56, 8); x56 -= l.x * x32; x56 -= l.y * x33; x56 -= l.z * x34; x56 -= l.w * x35; } { const v4f l = GDN_L4(56, 9); x56 -= l.x * x36; x56 -= l.y * x37; x56 -= l.z * x38; x56 -= l.w * x39; } { const v4f l = GDN_L4(56, 10); x56 -= l.x * x40; x56 -= l.y * x41; x56 -= l.z * x42; x56 -= l.w * x43; } { const v4f l = GDN_L4(56, 11); x56 -= l.x * x44; x56 -= l.y * x45; x56 -= l.z * x46; x56 -= l.w * x47; } { const v4f l = GDN_L4(56, 12); x56 -= l.x * x48; x56 -= l.y * x49; x56 -= l.z * x50; x56 -= l.w * x51; } { const v4f l = GDN_L4(56, 13); x56 -= l.x * x52; x56 -= l.y * x53; x56 -= l.z * x54; x56 -= l.w * x55; } __builtin_amdgcn_sched_barrier(0);
        float x57 = GDN_RHS(57); { const v4f l = GDN_L4(57, 0); x57 -= l.x * x0; x57 -= l.y * x1; x57 -= l.z * x2; x57 -= l.w * x3; } { const v4f l = GDN_L4(57, 1); x57 -= l.x * x4; x57 -= l.y * x5; x57 -= l.z * x6; x57 -= l.w * x7; } { const v4f l = GDN_L4(57, 2); x57 -= l.x * x8; x57 -= l.y * x9; x57 -= l.z * x10; x57 -= l.w * x11; } { const v4f l = GDN_L4(57, 3); x57 -= l.x * x12; x57 -= l.y * x13; x57 -= l.z * x14; x57 -= l.w * x15; } { const v4f l = GDN_L4(57, 4); x57 -= l.x * x16; x57 -= l.y * x17; x57 -= l.z * x18; x57 -= l.w * x19; } { const v4f l = GDN_L4(57, 5); x57 -= l.x * x20; x57 -= l.y * x21; x57 -= l.z * x22; x57 -= l.w * x23; } { const v4f l = GDN_L4(57, 6); x57 -= l.x * x24; x57 -= l.y * x25; x57 -= l.z * x26; x57 -= l.w * x27; } { const v4f l = GDN_L4(57, 7); x57 -= l.x * x28; x57 -= l.y * x29; x57 -= l.z * x30; x57 -= l.w * x31; } { const v4f l = GDN_L4(57, 8); x57 -= l.x * x32; x57 -= l.y * x33; x57 -= l.z * x34; x57 -= l.w * x35; } { const v4f l = GDN_L4(57, 9); x57 -= l.x * x36; x57 -= l.y * x37; x57 -= l.z * x38; x57 -= l.w * x39; } { const v4f l = GDN_L4(57, 10); x57 -= l.x * x40; x57 -= l.y * x41; x57 -= l.z * x42; x57 -= l.w * x43; } { const v4f l = GDN_L4(57, 11); x57 -= l.x * x44; x57 -= l.y * x45; x57 -= l.z * x46; x57 -= l.w * x47; } { const v4f l = GDN_L4(57, 12); x57 -= l.x * x48; x57 -= l.y * x49; x57 -= l.z * x50; x57 -= l.w * x51; } { const v4f l = GDN_L4(57, 13); x57 -= l.x * x52; x57 -= l.y * x53; x57 -= l.z * x54; x57 -= l.w * x55; } { const v4f l = GDN_L4(57, 14); x57 -= l.x * x56; } __builtin_amdgcn_sched_barrier(0);
        float x58 = GDN_RHS(58); { const v4f l = GDN_L4(58, 0); x58 -= l.x * x0; x58 -= l.y * x1; x58 -= l.z * x2; x58 -= l.w * x3; } { const v4f l = GDN_L4(58, 1); x58 -= l.x * x4; x58 -= l.y * x5; x58 -= l.z * x6; x58 -= l.w * x7; } { const v4f l = GDN_L4(58, 2); x58 -= l.x * x8; x58 -= l.y * x9; x58 -= l.z * x10; x58 -= l.w * x11; } { const v4f l = GDN_L4(58, 3); x58 -= l.x * x12; x58 -= l.y * x13; x58 -= l.z * x14; x58 -= l.w * x15; } { const v4f l = GDN_L4(58, 4); x58 -= l.x * x16; x58 -= l.y * x17; x58 -= l.z * x18; x58 -= l.w * x19; } { const v4f l = GDN_L4(58, 5); x58 -= l.x * x20; x58 -= l.y * x21; x58 -= l.z * x22; x58 -= l.w * x23; } { const v4f l = GDN_L4(58, 6); x58 -= l.x * x24; x58 -= l.y * x25; x58 -= l.z * x26; x58 -= l.w * x27; } { const v4f l = GDN_L4(58, 7); x58 -= l.x * x28; x58 -= l.y * x29; x58 -= l.z * x30; x58 -= l.w * x31; } { const v4f l = GDN_L4(58, 8); x58 -= l.x * x32; x58 -= l.y * x33; x58 -= l.z * x34; x58 -= l.w * x35; } { const v4f l = GDN_L4(58, 9); x58 -= l.x * x36; x58 -= l.y * x37; x58 -= l.z * x38; x58 -= l.w * x39; } { const v4f l = GDN_L4(58, 10); x58 -= l.x * x40; x58 -= l.y * x41; x58 -= l.z * x42; x58 -= l.w * x43; } { const v4f l = GDN_L4(58, 11); x58 -= l.x * x44; x58 -= l.y * x45; x58 -= l.z * x46; x58 -= l.w * x47; } { const v4f l = GDN_L4(58, 12); x58 -= l.x * x48; x58 -= l.y * x49; x58 -= l.z * x50; x58 -= l.w * x51; } { const v4f l = GDN_L4(58, 13); x58 -= l.x * x52; x58 -= l.y * x53; x58 -= l.z * x54; x58 -= l.w * x55; } { const v4f l = GDN_L4(58, 14); x58 -= l.x * x56; x58 -= l.y * x57; } __builtin_amdgcn_sched_barrier(0);
        float x59 = GDN_RHS(59); { const v4f l = GDN_L4(59, 0); x59 -= l.x * x0; x59 -= l.y * x1; x59 -= l.z * x2; x59 -= l.w * x3; } { const v4f l = GDN_L4(59, 1); x59 -= l.x * x4; x59 -= l.y * x5; x59 -= l.z * x6; x59 -= l.w * x7; } { const v4f l = GDN_L4(59, 2); x59 -= l.x * x8; x59 -= l.y * x9; x59 -= l.z * x10; x59 -= l.w * x11; } { const v4f l = GDN_L4(59, 3); x59 -= l.x * x12; x59 -= l.y * x13; x59 -= l.z * x14; x59 -= l.w * x15; } { const v4f l = GDN_L4(59, 4); x59 -= l.x * x16; x59 -= l.y * x17; x59 -= l.z * x18; x59 -= l.w * x19; } { const v4f l = GDN_L4(59, 5); x59 -= l.x * x20; x59 -= l.y * x21; x59 -= l.z * x22; x59 -= l.w * x23; } { const v4f l = GDN_L4(59, 6); x59 -= l.x * x24; x59 -= l.y * x25; x59 -= l.z * x26; x59 -= l.w * x27; } { const v4f l = GDN_L4(59, 7); x59 -= l.x * x28; x59 -= l.y * x29; x59 -= l.z * x30; x59 -= l.w * x31; } { const v4f l = GDN_L4(59, 8); x59 -= l.x * x32; x59 -= l.y * x33; x59 -= l.z * x34; x59 -= l.w * x35; } { const v4f l = GDN_L4(59, 9); x59 -= l.x * x36; x59 -= l.y * x37; x59 -= l.z * x38; x59 -= l.w * x39; } { const v4f l = GDN_L4(59, 10); x59 -= l.x * x40; x59 -= l.y * x41; x59 -= l.z * x42; x59 -= l.w * x43; } { const v4f l = GDN_L4(59, 11); x59 -= l.x * x44; x59 -= l.y * x45; x59 -= l.z * x46; x59 -= l.w * x47; } { const v4f l = GDN_L4(59, 12); x59 -= l.x * x48; x59 -= l.y * x49; x59 -= l.z * x50; x59 -= l.w * x51; } { const v4f l = GDN_L4(59, 13); x59 -= l.x * x52; x59 -= l.y * x53; x59 -= l.z * x54; x59 -= l.w * x55; } { const v4f l = GDN_L4(59, 14); x59 -= l.x * x56; x59 -= l.y * x57; x59 -= l.z * x58; } __builtin_amdgcn_sched_barrier(0);
        float x60 = GDN_RHS(60); { const v4f l = GDN_L4(60, 0); x60 -= l.x * x0; x60 -= l.y * x1; x60 -= l.z * x2; x60 -= l.w * x3; } { const v4f l = GDN_L4(60, 1); x60 -= l.x * x4; x60 -= l.y * x5; x60 -= l.z * x6; x60 -= l.w * x7; } { const v4f l = GDN_L4(60, 2); x60 -= l.x * x8; x60 -= l.y * x9; x60 -= l.z * x10; x60 -= l.w * x11; } { const v4f l = GDN_L4(60, 3); x60 -= l.x * x12; x60 -= l.y * x13; x60 -= l.z * x14; x60 -= l.w * x15; } { const v4f l = GDN_L4(60, 4); x60 -= l.x * x16; x60 -= l.y * x17; x60 -= l.z * x18; x60 -= l.w * x19; } { const v4f l = GDN_L4(60, 5); x60 -= l.x * x20; x60 -= l.y * x21; x60 -= l.z * x22; x60 -= l.w * x23; } { const v4f l = GDN_L4(60, 6); x60 -= l.x * x24; x60 -= l.y * x25; x60 -= l.z * x26; x60 -= l.w * x27; } { const v4f l = GDN_L4(60, 7); x60 -= l.x * x28; x60 -= l.y * x29; x60 -= l.z * x30; x60 -= l.w * x31; } { const v4f l = GDN_L4(60, 8); x60 -= l.x * x32; x60 -= l.y * x33; x60 -= l.z * x34; x60 -= l.w * x35; } { const v4f l = GDN_L4(60, 9); x60 -= l.x * x36; x60 -= l.y * x37; x60 -= l.z * x38; x60 -= l.w * x39; } { const v4f l = GDN_L4(60, 10); x60 -= l.x * x40; x60 -= l.y * x41; x60 -= l.z * x42; x60 -= l.w * x43; } { const v4f l = GDN_L4(60, 11); x60 -= l.x * x44; x60 -= l.y * x45; x60 -= l.z * x46; x60 -= l.w * x47; } { const v4f l = GDN_L4(60, 12); x60 -= l.x * x48; x60 -= l.y * x49; x60 -= l.z * x50; x60 -= l.w * x51; } { const v4f l = GDN_L4(60, 13); x60 -= l.x * x52; x60 -= l.y * x53; x60 -= l.z * x54; x60 -= l.w * x55; } { const v4f l = GDN_L4(60, 14); x60 -= l.x * x56; x60 -= l.y * x57; x60 -= l.z * x58; x60 -= l.w * x59; } __builtin_amdgcn_sched_barrier(0);
        float x61 = GDN_RHS(61); { const v4f l = GDN_L4(61, 0); x61 -= l.x * x0; x61 -= l.y * x1; x61 -= l.z * x2; x61 -= l.w * x3; } { const v4f l = GDN_L4(61, 1); x61 -= l.x * x4; x61 -= l.y * x5; x61 -= l.z * x6; x61 -= l.w * x7; } { const v4f l = GDN_L4(61, 2); x61 -= l.x * x8; x61 -= l.y * x9; x61 -= l.z * x10; x61 -= l.w * x11; } { const v4f l = GDN_L4(61, 3); x61 -= l.x * x12; x61 -= l.y * x13; x61 -= l.z * x14; x61 -= l.w * x15; } { const v4f l = GDN_L4(61, 4); x61 -= l.x * x16; x61 -= l.y * x17; x61 -= l.z * x18; x61 -= l.w * x19; } { const v4f l = GDN_L4(61, 5); x61 -= l.x * x20; x61 -= l.y * x21; x61 -= l.z * x22; x61 -= l.w * x23; } { const v4f l = GDN_L4(61, 6); x61 -= l.x * x24; x61 -= l.y * x25; x61 -= l.z * x26; x61 -= l.w * x27; } { const v4f l = GDN_L4(61, 7); x61 -= l.x * x28; x61 -= l.y * x29; x61 -= l.z * x30; x61 -= l.w * x31; } { const v4f l = GDN_L4(61, 8); x61 -= l.x * x32; x61 -= l.y * x33; x61 -= l.z * x34; x61 -= l.w * x35; } { const v4f l = GDN_L4(61, 9); x61 -= l.x * x36; x61 -= l.y * x37; x61 -= l.z * x38; x61 -= l.w * x39; } { const v4f l = GDN_L4(61, 10); x61 -= l.x * x40; x61 -= l.y * x41; x61 -= l.z * x42; x61 -= l.w * x43; } { const v4f l = GDN_L4(61, 11); x61 -= l.x * x44; x61 -= l.y * x45; x61 -= l.z * x46; x61 -= l.w * x47; } { const v4f l = GDN_L4(61, 12); x61 -= l.x * x48; x61 -= l.y * x49; x61 -= l.z * x50; x61 -= l.w * x51; } { const v4f l = GDN_L4(61, 13); x61 -= l.x * x52; x61 -= l.y * x53; x61 -= l.z * x54; x61 -= l.w * x55; } { const v4f l = GDN_L4(61, 14); x61 -= l.x * x56; x61 -= l.y * x57; x61 -= l.z * x58; x61 -= l.w * x59; } { const v4f l = GDN_L4(61, 15); x61 -= l.x * x60; } __builtin_amdgcn_sched_barrier(0);
        float x62 = GDN_RHS(62); { const v4f l = GDN_L4(62, 0); x62 -= l.x * x0; x62 -= l.y * x1; x62 -= l.z * x2; x62 -= l.w * x3; } { const v4f l = GDN_L4(62, 1); x62 -= l.x * x4; x62 -= l.y * x5; x62 -= l.z * x6; x62 -= l.w * x7; } { const v4f l = GDN_L4(62, 2); x62 -= l.x * x8; x62 -= l.y * x9; x62 -= l.z * x10; x62 -= l.w * x11; } { const v4f l = GDN_L4(62, 3); x62 -= l.x * x12; x62 -= l.y * x13; x62 -= l.z * x14; x62 -= l.w * x15; } { const v4f l = GDN_L4(62, 4); x62 -= l.x * x16; x62 -= l.y * x17; x62 -= l.z * x18; x62 -= l.w * x19; } { const v4f l = GDN_L4(62, 5); x62 -= l.x * x20; x62 -= l.y * x21; x62 -= l.z * x22; x62 -= l.w * x23; } { const v4f l = GDN_L4(62, 6); x62 -= l.x * x24; x62 -= l.y * x25; x62 -= l.z * x26; x62 -= l.w * x27; } { const v4f l = GDN_L4(62, 7); x62 -= l.x * x28; x62 -= l.y * x29; x62 -= l.z * x30; x62 -= l.w * x31; } { const v4f l = GDN_L4(62, 8); x62 -= l.x * x32; x62 -= l.y * x33; x62 -= l.z * x34; x62 -= l.w * x35; } { const v4f l = GDN_L4(62, 9); x62 -= l.x * x36; x62 -= l.y * x37; x62 -= l.z * x38; x62 -= l.w * x39; } { const v4f l = GDN_L4(62, 10); x62 -= l.x * x40; x62 -= l.y * x41; x62 -= l.z * x42; x62 -= l.w * x43; } { const v4f l = GDN_L4(62, 11); x62 -= l.x * x44; x62 -= l.y * x45; x62 -= l.z * x46; x62 -= l.w * x47; } { const v4f l = GDN_L4(62, 12); x62 -= l.x * x48; x62 -= l.y * x49; x62 -= l.z * x50; x62 -= l.w * x51; } { const v4f l = GDN_L4(62, 13); x62 -= l.x * x52; x62 -= l.y * x53; x62 -= l.z * x54; x62 -= l.w * x55; } { const v4f l = GDN_L4(62, 14); x62 -= l.x * x56; x62 -= l.y * x57; x62 -= l.z * x58; x62 -= l.w * x59; } { const v4f l = GDN_L4(62, 15); x62 -= l.x * x60; x62 -= l.y * x61; } __builtin_amdgcn_sched_barrier(0);
        float x63 = GDN_RHS(63); { const v4f l = GDN_L4(63, 0); x63 -= l.x * x0; x63 -= l.y * x1; x63 -= l.z * x2; x63 -= l.w * x3; } { const v4f l = GDN_L4(63, 1); x63 -= l.x * x4; x63 -= l.y * x5; x63 -= l.z * x6; x63 -= l.w * x7; } { const v4f l = GDN_L4(63, 2); x63 -= l.x * x8; x63 -= l.y * x9; x63 -= l.z * x10; x63 -= l.w * x11; } { const v4f l = GDN_L4(63, 3); x63 -= l.x * x12; x63 -= l.y * x13; x63 -= l.z * x14; x63 -= l.w * x15; } { const v4f l = GDN_L4(63, 4); x63 -= l.x * x16; x63 -= l.y * x17; x63 -= l.z * x18; x63 -= l.w * x19; } { const v4f l = GDN_L4(63, 5); x63 -= l.x * x20; x63 -= l.y * x21; x63 -= l.z * x22; x63 -= l.w * x23; } { const v4f l = GDN_L4(63, 6); x63 -= l.x * x24; x63 -= l.y * x25; x63 -= l.z * x26; x63 -= l.w * x27; } { const v4f l = GDN_L4(63, 7); x63 -= l.x * x28; x63 -= l.y * x29; x63 -= l.z * x30; x63 -= l.w * x31; } { const v4f l = GDN_L4(63, 8); x63 -= l.x * x32; x63 -= l.y * x33; x63 -= l.z * x34; x63 -= l.w * x35; } { const v4f l = GDN_L4(63, 9); x63 -= l.x * x36; x63 -= l.y * x37; x63 -= l.z * x38; x63 -= l.w * x39; } { const v4f l = GDN_L4(63, 10); x63 -= l.x * x40; x63 -= l.y * x41; x63 -= l.z * x42; x63 -= l.w * x43; } { const v4f l = GDN_L4(63, 11); x63 -= l.x * x44; x63 -= l.y * x45; x63 -= l.z * x46; x63 -= l.w * x47; } { const v4f l = GDN_L4(63, 12); x63 -= l.x * x48; x63 -= l.y * x49; x63 -= l.z * x50; x63 -= l.w * x51; } { const v4f l = GDN_L4(63, 13); x63 -= l.x * x52; x63 -= l.y * x53; x63 -= l.z * x54; x63 -= l.w * x55; } { const v4f l = GDN_L4(63, 14); x63 -= l.x * x56; x63 -= l.y * x57; x63 -= l.z * x58; x63 -= l.w * x59; } { const v4f l = GDN_L4(63, 15); x63 -= l.x * x60; x63 -= l.y * x61; x63 -= l.z * x62; } __builtin_amdgcn_sched_barrier(0);
        if (c < 128) { GU[0 * 128 + c] = x0; GU[1 * 128 + c] = x1; GU[2 * 128 + c] = x2; GU[3 * 128 + c] = x3; GU[4 * 128 + c] = x4; GU[5 * 128 + c] = x5; GU[6 * 128 + c] = x6; GU[7 * 128 + c] = x7; GU[8 * 128 + c] = x8; GU[9 * 128 + c] = x9; GU[10 * 128 + c] = x10; GU[11 * 128 + c] = x11; GU[12 * 128 + c] = x12; GU[13 * 128 + c] = x13; GU[14 * 128 + c] = x14; GU[15 * 128 + c] = x15; GU[16 * 128 + c] = x16; GU[17 * 128 + c] = x17; GU[18 * 128 + c] = x18; GU[19 * 128 + c] = x19; GU[20 * 128 + c] = x20; GU[21 * 128 + c] = x21; GU[22 * 128 + c] = x22; GU[23 * 128 + c] = x23; GU[24 * 128 + c] = x24; GU[25 * 128 + c] = x25; GU[26 * 128 + c] = x26; GU[27 * 128 + c] = x27; GU[28 * 128 + c] = x28; GU[29 * 128 + c] = x29; GU[30 * 128 + c] = x30; GU[31 * 128 + c] = x31; GU[32 * 128 + c] = x32; GU[33 * 128 + c] = x33; GU[34 * 128 + c] = x34; GU[35 * 128 + c] = x35; GU[36 * 128 + c] = x36; GU[37 * 128 + c] = x37; GU[38 * 128 + c] = x38; GU[39 * 128 + c] = x39; GU[40 * 128 + c] = x40; GU[41 * 128 + c] = x41; GU[42 * 128 + c] = x42; GU[43 * 128 + c] = x43; GU[44 * 128 + c] = x44; GU[45 * 128 + c] = x45; GU[46 * 128 + c] = x46; GU[47 * 128 + c] = x47; GU[48 * 128 + c] = x48; GU[49 * 128 + c] = x49; GU[50 * 128 + c] = x50; GU[51 * 128 + c] = x51; GU[52 * 128 + c] = x52; GU[53 * 128 + c] = x53; GU[54 * 128 + c] = x54; GU[55 * 128 + c] = x55; GU[56 * 128 + c] = x56; GU[57 * 128 + c] = x57; GU[58 * 128 + c] = x58; GU[59 * 128 + c] = x59; GU[60 * 128 + c] = x60; GU[61 * 128 + c] = x61; GU[62 * 128 + c] = x62; GU[63 * 128 + c] = x63; }
        else { GNW[0 * 128 + (c - 128)] = (bf16)f2bf(-x0); GNW[1 * 128 + (c - 128)] = (bf16)f2bf(-x1); GNW[2 * 128 + (c - 128)] = (bf16)f2bf(-x2); GNW[3 * 128 + (c - 128)] = (bf16)f2bf(-x3); GNW[4 * 128 + (c - 128)] = (bf16)f2bf(-x4); GNW[5 * 128 + (c - 128)] = (bf16)f2bf(-x5); GNW[6 * 128 + (c - 128)] = (bf16)f2bf(-x6); GNW[7 * 128 + (c - 128)] = (bf16)f2bf(-x7); GNW[8 * 128 + (c - 128)] = (bf16)f2bf(-x8); GNW[9 * 128 + (c - 128)] = (bf16)f2bf(-x9); GNW[10 * 128 + (c - 128)] = (bf16)f2bf(-x10); GNW[11 * 128 + (c - 128)] = (bf16)f2bf(-x11); GNW[12 * 128 + (c - 128)] = (bf16)f2bf(-x12); GNW[13 * 128 + (c - 128)] = (bf16)f2bf(-x13); GNW[14 * 128 + (c - 128)] = (bf16)f2bf(-x14); GNW[15 * 128 + (c - 128)] = (bf16)f2bf(-x15); GNW[16 * 128 + (c - 128)] = (bf16)f2bf(-x16); GNW[17 * 128 + (c - 128)] = (bf16)f2bf(-x17); GNW[18 * 128 + (c - 128)] = (bf16)f2bf(-x18); GNW[19 * 128 + (c - 128)] = (bf16)f2bf(-x19); GNW[20 * 128 + (c - 128)] = (bf16)f2bf(-x20); GNW[21 * 128 + (c - 128)] = (bf16)f2bf(-x21); GNW[22 * 128 + (c - 128)] = (bf16)f2bf(-x22); GNW[23 * 128 + (c - 128)] = (bf16)f2bf(-x23); GNW[24 * 128 + (c - 128)] = (bf16)f2bf(-x24); GNW[25 * 128 + (c - 128)] = (bf16)f2bf(-x25); GNW[26 * 128 + (c - 128)] = (bf16)f2bf(-x26); GNW[27 * 128 + (c - 128)] = (bf16)f2bf(-x27); GNW[28 * 128 + (c - 128)] = (bf16)f2bf(-x28); GNW[29 * 128 + (c - 128)] = (bf16)f2bf(-x29); GNW[30 * 128 + (c - 128)] = (bf16)f2bf(-x30); GNW[31 * 128 + (c - 128)] = (bf16)f2bf(-x31); GNW[32 * 128 + (c - 128)] = (bf16)f2bf(-x32); GNW[33 * 128 + (c - 128)] = (bf16)f2bf(-x33); GNW[34 * 128 + (c - 128)] = (bf16)f2bf(-x34); GNW[35 * 128 + (c - 128)] = (bf16)f2bf(-x35); GNW[36 * 128 + (c - 128)] = (bf16)f2bf(-x36); GNW[37 * 128 + (c - 128)] = (bf16)f2bf(-x37); GNW[38 * 128 + (c - 128)] = (bf16)f2bf(-x38); GNW[39 * 128 + (c - 128)] = (bf16)f2bf(-x39); GNW[40 * 128 + (c - 128)] = (bf16)f2bf(-x40); GNW[41 * 128 + (c - 128)] = (bf16)f2bf(-x41); GNW[42 * 128 + (c - 128)] = (bf16)f2bf(-x42); GNW[43 * 128 + (c - 128)] = (bf16)f2bf(-x43); GNW[44 * 128 + (c - 128)] = (bf16)f2bf(-x44); GNW[45 * 128 + (c - 128)] = (bf16)f2bf(-x45); GNW[46 * 128 + (c - 128)] = (bf16)f2bf(-x46); GNW[47 * 128 + (c - 128)] = (bf16)f2bf(-x47); GNW[48 * 128 + (c - 128)] = (bf16)f2bf(-x48); GNW[49 * 128 + (c - 128)] = (bf16)f2bf(-x49); GNW[50 * 128 + (c - 128)] = (bf16)f2bf(-x50); GNW[51 * 128 + (c - 128)] = (bf16)f2bf(-x51); GNW[52 * 128 + (c - 128)] = (bf16)f2bf(-x52); GNW[53 * 128 + (c - 128)] = (bf16)f2bf(-x53); GNW[54 * 128 + (c - 128)] = (bf16)f2bf(-x54); GNW[55 * 128 + (c - 128)] = (bf16)f2bf(-x55); GNW[56 * 128 + (c - 128)] = (bf16)f2bf(-x56); GNW[57 * 128 + (c - 128)] = (bf16)f2bf(-x57); GNW[58 * 128 + (c - 128)] = (bf16)f2bf(-x58); GNW[59 * 128 + (c - 128)] = (bf16)f2bf(-x59); GNW[60 * 128 + (c - 128)] = (bf16)f2bf(-x60); GNW[61 * 128 + (c - 128)] = (bf16)f2bf(-x61); GNW[62 * 128 + (c - 128)] = (bf16)f2bf(-x62); GNW[63 * 128 + (c - 128)] = (bf16)f2bf(-x63); }
#undef GDN_RHS
#undef GDN_L4
    } else {
        const int t2 = tid - 256; const float gl = gcs[63];
        { const int i = t2 >> 2, d0 = (t2 & 3) * 32; const float e = __expf(gcs[i]);
#pragma unroll
          for (int x8 = 0; x8 < 4; ++x8) { const v4f a = *(const LAS v4f*)(qs + i * QP + d0 + 8 * x8), b = *(const LAS v4f*)(qs + i * QP + d0 + 8 * x8 + 4);
              v4u w; w.x = pk2(a.x * e, a.y * e); w.y = pk2(a.z * e, a.w * e); w.z = pk2(b.x * e, b.y * e); w.w = pk2(b.z * e, b.w * e); *(v4u*)(GQG + i * 128 + d0 + 8 * x8) = w; } }
        { const int d = t2 >> 1, j0 = (t2 & 1) * 32;
#pragma unroll
          for (int x8 = 0; x8 < 4; ++x8) { float o[8];
#pragma unroll
              for (int x = 0; x < 8; ++x) { const int j = j0 + 8 * x8 + x; o[x] = ks[j * QP + d] * __expf(gl - gcs[j]); }
              v4u w; w.x = pk2(o[0], o[1]); w.y = pk2(o[2], o[3]); w.z = pk2(o[4], o[5]); w.w = pk2(o[6], o[7]); *(v4u*)(GKT + d * 64 + j0 + 8 * x8) = w; } }
        if (t2 == 0) GDL[item] = __expf(gl);
    }
    __syncthreads();
}
struct GdnFrags { bf16x8_t nw[4], qg[4], at[2], kt[2][2]; float u[4]; float dl; };
__device__ __forceinline__ void gdn_load(GdnFrags& F, const Params& p, int item, int off128, int off64, int offk, int offu) {
    const bf16* GNW = (const bf16*)(p.ws + WS_GNW) + (size_t)item * 8192; const bf16* GQG = (const bf16*)(p.ws + WS_GQG) + (size_t)item * 8192;
    const bf16* GAT = (const bf16*)(p.ws + WS_GAT) + (size_t)item * 4096; const bf16* GKT = (const bf16*)(p.ws + WS_GKT) + (size_t)item * 8192; const float* GU = (const float*)(p.ws + WS_GU) + (size_t)item * 8192;
#pragma unroll
    for (int ks = 0; ks < 4; ++ks) { F.nw[ks] = *(const bf16x8_t*)(GNW + off128 + 32 * ks); F.qg[ks] = *(const bf16x8_t*)(GQG + off128 + 32 * ks); }
#pragma unroll
    for (int ks = 0; ks < 2; ++ks) { F.at[ks] = *(const bf16x8_t*)(GAT + off64 + 32 * ks); F.kt[0][ks] = *(const bf16x8_t*)(GKT + offk + 32 * ks); F.kt[1][ks] = *(const bf16x8_t*)(GKT + offk + 1024 + 32 * ks); }
#pragma unroll
    for (int r = 0; r < 4; ++r) F.u[r] = GU[offu + r * 128];
    F.dl = ((const float*)(p.ws + WS_GDL))[item];
}
constexpr int STP = 136, VNP = 72;
__device__ __forceinline__ void gdn_seq(const Params& p, LAS unsigned char* lds, int wgi, int wave, int lane) {
    const int u = wgi * 2 + (wave >> 2), wi = wave & 3, h = u >> 3, sl = u & 7, g = lane >> 4, c = lane & 15;
    LAS unsigned short* ST = (LAS unsigned short*)(lds + (wave >> 2) * 12288);
    LAS unsigned short* VNT = ST + 2 * 16 * STP;
    float* GO = (float*)(p.ws + WS_GO);
    const int off128 = (16 * wi + c) * 128 + 8 * g, off64 = (16 * wi + c) * 64 + 8 * g, offk = (32 * wi + c) * 64 + 8 * g, offu = (16 * wi + 4 * g) * 128 + 16 * sl + c;
#pragma unroll
    for (int mt = 0; mt < 2; ++mt) *(LAS v2u*)(ST + c * STP + 16 * (2 * wi + mt) + 4 * g) = (v2u){0u, 0u};
    pg8::f32x4 Sacc[2] = {{0.f, 0.f, 0.f, 0.f}, {0.f, 0.f, 0.f, 0.f}};
    __syncthreads();
    GdnFrags F0, F1;
    gdn_load(F0, p, h, off128, off64, offk, offu);
#define GDN_STEP(F, n_) do { const int cur = (n_) & 1; bf16x8_t sf[4]; \
        _Pragma("unroll") for (int ks = 0; ks < 4; ++ks) sf[ks] = *(const LAS bf16x8_t*)(ST + cur * 16 * STP + c * STP + 32 * ks + 8 * g); \
        pg8::f32x4 vn = {F.u[0], F.u[1], F.u[2], F.u[3]}; \
        _Pragma("unroll") for (int ks = 0; ks < 4; ++ks) vn = __builtin_amdgcn_mfma_f32_16x16x32_bf16(F.nw[ks], sf[ks], vn, 0, 0, 0); \
        { v2u w; w.x = pk2(vn[0], vn[1]); w.y = pk2(vn[2], vn[3]); *(LAS v2u*)(VNT + c * VNP + 16 * wi + 4 * g) = w; } \
        LDS_BAR(); \
        const bf16x8_t v0 = *(const LAS bf16x8_t*)(VNT + c * VNP + 8 * g), v1 = *(const LAS bf16x8_t*)(VNT + c * VNP + 32 + 8 * g); \
        pg8::f32x4 o = {0.f, 0.f, 0.f, 0.f}; \
        _Pragma("unroll") for (int ks = 0; ks < 4; ++ks) o = __builtin_amdgcn_mfma_f32_16x16x32_bf16(F.qg[ks], sf[ks], o, 0, 0, 0); \
        o = __builtin_amdgcn_mfma_f32_16x16x32_bf16(F.at[0], v0, o, 0, 0, 0); o = __builtin_amdgcn_mfma_f32_16x16x32_bf16(F.at[1], v1, o, 0, 0, 0); \
        { const size_t tb = (size_t)(n_) * 64 + 16 * wi + 4 * g; _Pragma("unroll") for (int r = 0; r < 4; ++r) GO[(tb + r) * BW + h * 128 + 16 * sl + c] = o[r]; } \
        _Pragma("unroll") for (int mt = 0; mt < 2; ++mt) { Sacc[mt] = Sacc[mt] * F.dl; \
            Sacc[mt] = __builtin_amdgcn_mfma_f32_16x16x32_bf16(F.kt[mt][0], v0, Sacc[mt], 0, 0, 0); Sacc[mt] = __builtin_amdgcn_mfma_f32_16x16x32_bf16(F.kt[mt][1], v1, Sacc[mt], 0, 0, 0); \
            v2u w; w.x = pk2(Sacc[mt][0], Sacc[mt][1]); w.y = pk2(Sacc[mt][2], Sacc[mt][3]); *(LAS v2u*)(ST + (cur ^ 1) * 16 * STP + c * STP + 16 * (2 * wi + mt) + 4 * g) = w; } \
        LDS_BAR(); } while (0)
    for (int n = 0; n < T / 64; n += 2) {
        gdn_load(F1, p, (n + 1) * 4 + h, off128, off64, offk, offu);
        GDN_STEP(F0, n);
        gdn_load(F0, p, ((n + 2 < T / 64) ? n + 2 : n) * 4 + h, off128, off64, offk, offu);
        GDN_STEP(F1, n + 1);
    }
#undef GDN_STEP
}

constexpr int SEQ_UOFF = 132096;
constexpr int GI_NW = 0, GI_QG = 8704, GI_AT = 17408, GI_KT = 22016, GI_SZ = 31232;
struct GdnStage { v4u r[7]; float u[4]; float dl; };
__device__ __forceinline__ void gdn_stage_load(GdnStage& Sg, const Params& p, int item, int tid, int offu) {
    const bf16* GNW = (const bf16*)(p.ws + WS_GNW) + (size_t)item * 8192; const bf16* GQG = (const bf16*)(p.ws + WS_GQG) + (size_t)item * 8192;
    const bf16* GAT = (const bf16*)(p.ws + WS_GAT) + (size_t)item * 4096; const bf16* GKT = (const bf16*)(p.ws + WS_GKT) + (size_t)item * 8192; const float* GU = (const float*)(p.ws + WS_GU) + (size_t)item * 8192;
    Sg.r[0] = *(const v4u*)(GNW + 8 * tid); Sg.r[1] = *(const v4u*)(GNW + 8 * (tid + 512)); Sg.r[2] = *(const v4u*)(GQG + 8 * tid); Sg.r[3] = *(const v4u*)(GQG + 8 * (tid + 512));
    Sg.r[4] = *(const v4u*)(GAT + 8 * tid); Sg.r[5] = *(const v4u*)(GKT + 8 * tid); Sg.r[6] = *(const v4u*)(GKT + 8 * (tid + 512));
#pragma unroll
    for (int r = 0; r < 4; ++r) Sg.u[r] = GU[offu + r * 128];
    Sg.dl = ((const float*)(p.ws + WS_GDL))[item];
}
__device__ __forceinline__ void gdn_stage_write(const GdnStage& Sg, LAS unsigned short* img, int tid) {
    { const int p0 = tid, p1 = tid + 512;
      *(LAS v4u*)(img + GI_NW + (p0 >> 4) * 136 + 8 * (p0 & 15)) = Sg.r[0]; *(LAS v4u*)(img + GI_NW + (p1 >> 4) * 136 + 8 * (p1 & 15)) = Sg.r[1];
      *(LAS v4u*)(img + GI_QG + (p0 >> 4) * 136 + 8 * (p0 & 15)) = Sg.r[2]; *(LAS v4u*)(img + GI_QG + (p1 >> 4) * 136 + 8 * (p1 & 15)) = Sg.r[3];
      *(LAS v4u*)(img + GI_AT + (p0 >> 3) * 72 + 8 * (p0 & 7)) = Sg.r[4];
      *(LAS v4u*)(img + GI_KT + (p0 >> 3) * 72 + 8 * (p0 & 7)) = Sg.r[5]; *(LAS v4u*)(img + GI_KT + (p1 >> 3) * 72 + 8 * (p1 & 7)) = Sg.r[6]; }
}
__device__ __forceinline__ void gdn_seq2(const Params& p, LAS unsigned char* lds, int wgi, int tid, int wave, int lane) {
    const int h = wgi >> 2, sl = 2 * (wgi & 3) + (wave >> 2), wi = wave & 3, g = lane >> 4, c = lane & 15;
    LAS unsigned short* IMG = (LAS unsigned short*)lds;
    LAS unsigned short* ST = (LAS unsigned short*)(lds + SEQ_UOFF + (wave >> 2) * 12288);
    LAS unsigned short* VNT = ST + 2 * 16 * STP;
    float* GO = (float*)(p.ws + WS_GO);
    const int offu = (16 * wi + 4 * g) * 128 + 16 * sl + c;
#pragma unroll
    for (int mt = 0; mt < 2; ++mt) *(LAS v2u*)(ST + c * STP + 16 * (2 * wi + mt) + 4 * g) = (v2u){0u, 0u};
    pg8::f32x4 Sacc[2] = {{0.f, 0.f, 0.f, 0.f}, {0.f, 0.f, 0.f, 0.f}};
    GdnStage A, B;
    gdn_stage_load(A, p, h, tid, offu); gdn_stage_write(A, IMG, tid);
    gdn_stage_load(B, p, 4 + h, tid, offu);
    LDS_BAR();
    constexpr int NCH = T / 64;
#define GDN_STEP2(X, Y, n_) do { const int cur = (n_) & 1; const LAS unsigned short* im = IMG + cur * GI_SZ; bf16x8_t sf[4]; \
        _Pragma("unroll") for (int ks = 0; ks < 4; ++ks) sf[ks] = *(const LAS bf16x8_t*)(ST + cur * 16 * STP + c * STP + 32 * ks + 8 * g); \
        pg8::f32x4 vn = {X.u[0], X.u[1], X.u[2], X.u[3]}; const float dl = X.dl; \
        _Pragma("unroll") for (int ks = 0; ks < 4; ++ks) vn = __builtin_amdgcn_mfma_f32_16x16x32_bf16(*(const LAS bf16x8_t*)(im + GI_NW + (16 * wi + c) * 136 + 32 * ks + 8 * g), sf[ks], vn, 0, 0, 0); \
        { v2u w; w.x = pk2(vn[0], vn[1]); w.y = pk2(vn[2], vn[3]); *(LAS v2u*)(VNT + c * VNP + 16 * wi + 4 * g) = w; } \
        pg8::f32x4 o = {0.f, 0.f, 0.f, 0.f}; \
        _Pragma("unroll") for (int ks = 0; ks < 4; ++ks) o = __builtin_amdgcn_mfma_f32_16x16x32_bf16(*(const LAS bf16x8_t*)(im + GI_QG + (16 * wi + c) * 136 + 32 * ks + 8 * g), sf[ks], o, 0, 0, 0); \
        LDS_BAR(); \
        gdn_stage_load(X, p, (((n_) + 2 < NCH) ? (n_) + 2 : (n_)) * 4 + h, tid, offu); \
        const bf16x8_t v0 = *(const LAS bf16x8_t*)(VNT + c * VNP + 8 * g), v1 = *(const LAS bf16x8_t*)(VNT + c * VNP + 32 + 8 * g); \
        o = __builtin_amdgcn_mfma_f32_16x16x32_bf16(*(const LAS bf16x8_t*)(im + GI_AT + (16 * wi + c) * 72 + 8 * g), v0, o, 0, 0, 0); \
        o = __builtin_amdgcn_mfma_f32_16x16x32_bf16(*(const LAS bf16x8_t*)(im + GI_AT + (16 * wi + c) * 72 + 32 + 8 * g), v1, o, 0, 0, 0); \
        { const size_t tb = (size_t)(n_) * 64 + 16 * wi + 4 * g; _Pragma("unroll") for (int r = 0; r < 4; ++r) GO[(tb + r) * BW + h * 128 + 16 * sl + c] = o[r]; } \
        _Pragma("unroll") for (int mt = 0; mt < 2; ++mt) { Sacc[mt] = Sacc[mt] * dl; \
            Sacc[mt] = __builtin_amdgcn_mfma_f32_16x16x32_bf16(*(const LAS bf16x8_t*)(im + GI_KT + (16 * (2 * wi + mt) + c) * 72 + 8 * g), v0, Sacc[mt], 0, 0, 0); \
            Sacc[mt] = __builtin_amdgcn_mfma_f32_16x16x32_bf16(*(const LAS bf16x8_t*)(im + GI_KT + (16 * (2 * wi + mt) + c) * 72 + 32 + 8 * g), v1, Sacc[mt], 0, 0, 0); \
            v2u w; w.x = pk2(Sacc[mt][0], Sacc[mt][1]); w.y = pk2(Sacc[mt][2], Sacc[mt][3]); *(LAS v2u*)(ST + (cur ^ 1) * 16 * STP + c * STP + 16 * (2 * wi + mt) + 4 * g) = w; } \
        gdn_stage_write(Y, IMG + (cur ^ 1) * GI_SZ, tid); \
        LDS_BAR(); } while (0)
    for (int n = 0; n < NCH; n += 2) { GDN_STEP2(A, B, n); GDN_STEP2(B, A, n + 1); }
#undef GDN_STEP2
}
constexpr int MI_Q = 0, MI_S = 4608, MI_K = 9216, MI_SZ = 13824;
struct MlStage { v4u r[3]; bf16x8_t vt[2]; float fl; };
__device__ __forceinline__ void ml_stage_load(MlStage& Sg, const Params& p, int item, int tid, int offV) {
    const bf16* MQ = (const bf16*)(p.ws + WS_MQ) + (size_t)item * 4096; const bf16* MS = (const bf16*)(p.ws + WS_MS) + (size_t)item * 4096; const bf16* MK = (const bf16*)(p.ws + WS_MK) + (size_t)item * 4096;
    const bf16* MV = (const bf16*)(p.ws + WS_MV) + (size_t)item * 9216;
    Sg.r[0] = *(const v4u*)(MQ + 8 * tid); Sg.r[1] = *(const v4u*)(MS + 8 * tid); Sg.r[2] = *(const v4u*)(MK + 8 * tid);
    Sg.vt[0] = *(const bf16x8_t*)(MV + offV); Sg.vt[1] = *(const bf16x8_t*)(MV + offV + 32);
    Sg.fl = ((const float*)(p.ws + WS_MFL))[item];
}
__device__ __forceinline__ void ml_stage_write(const MlStage& Sg, LAS unsigned short* img, int tid) {
    const int o = (tid >> 3) * 72 + 8 * (tid & 7);
    *(LAS v4u*)(img + MI_Q + o) = Sg.r[0]; *(LAS v4u*)(img + MI_S + o) = Sg.r[1]; *(LAS v4u*)(img + MI_K + o) = Sg.r[2];
}
__device__ __forceinline__ void ml_seq2(const Params& p, LAS unsigned char* lds, int wgi, int tid, int wave, int lane) {
    const int h = wgi / 5, sl0 = 2 * (wgi % 5) + (wave >> 2), wi = wave & 3, g = lane >> 4, c = lane & 15;
    const bool real = sl0 < 9; const int sl = real ? sl0 : 8;
    LAS unsigned short* IMG = (LAS unsigned short*)lds;
    LAS unsigned short* CT = (LAS unsigned short*)(lds + SEQ_UOFF + (wave >> 2) * 8192);
    float* HO = (float*)(p.ws + WS_HO); float* HDEN = (float*)(p.ws + WS_HDEN);
    const int offV = (16 * sl + c) * 64 + 8 * g;
    *(LAS v2u*)(CT + c * 72 + 16 * wi + 4 * g) = (v2u){0u, 0u};
    pg8::f32x4 Cacc = {0.f, 0.f, 0.f, 0.f};
    MlStage A, B;
    ml_stage_load(A, p, h, tid, offV); ml_stage_write(A, IMG, tid);
    ml_stage_load(B, p, 4 + h, tid, offV);
    LDS_BAR();
    constexpr int NCH = T / 64;
#define ML_STEP2(X, Y, n_) do { const int cur = (n_) & 1; const LAS unsigned short* im = IMG + cur * MI_SZ; const int ro = (16 * wi + c) * 72 + 8 * g; \
        const bf16x8_t c0 = *(const LAS bf16x8_t*)(CT + cur * 16 * 72 + c * 72 + 8 * g), c1 = *(const LAS bf16x8_t*)(CT + cur * 16 * 72 + c * 72 + 32 + 8 * g); \
        const bf16x8_t vt0 = X.vt[0], vt1 = X.vt[1]; const float fl = X.fl; \
        pg8::f32x4 num = {0.f, 0.f, 0.f, 0.f}; \
        num = __builtin_amdgcn_mfma_f32_16x16x32_bf16(*(const LAS bf16x8_t*)(im + MI_Q + ro), c0, num, 0, 0, 0); num = __builtin_amdgcn_mfma_f32_16x16x32_bf16(*(const LAS bf16x8_t*)(im + MI_Q + ro + 32), c1, num, 0, 0, 0); \
        num = __builtin_amdgcn_mfma_f32_16x16x32_bf16(*(const LAS bf16x8_t*)(im + MI_S + ro), vt0, num, 0, 0, 0); num = __builtin_amdgcn_mfma_f32_16x16x32_bf16(*(const LAS bf16x8_t*)(im + MI_S + ro + 32), vt1, num, 0, 0, 0); \
        Cacc = Cacc * fl; \
        Cacc = __builtin_amdgcn_mfma_f32_16x16x32_bf16(*(const LAS bf16x8_t*)(im + MI_K + ro), vt0, Cacc, 0, 0, 0); Cacc = __builtin_amdgcn_mfma_f32_16x16x32_bf16(*(const LAS bf16x8_t*)(im + MI_K + ro + 32), vt1, Cacc, 0, 0, 0); \
        ml_stage_load(X, p, (((n_) + 2 < NCH) ? (n_) + 2 : (n_)) * 4 + h, tid, offV); \
        { v2u w; w.x = pk2(Cacc[0], Cacc[1]); w.y = pk2(Cacc[2], Cacc[3]); *(LAS v2u*)(CT + (cur ^ 1) * 16 * 72 + c * 72 + 16 * wi + 4 * g) = w; } \
        { const size_t tb = (size_t)(n_) * 64 + 16 * wi + 4 * g; \
          if (sl < 8) { _Pragma("unroll") for (int r = 0; r < 4; ++r) HO[(tb + r) * BW + h * 128 + 16 * sl + c] = num[r]; } \
          else if (c == 0 && real) { _Pragma("unroll") for (int r = 0; r < 4; ++r) HDEN[(tb + r) * 4 + h] = num[r]; } } \
        ml_stage_write(Y, IMG + (cur ^ 1) * MI_SZ, tid); \
        LDS_BAR(); } while (0)
    for (int n = 0; n < NCH; n += 2) { ML_STEP2(A, B, n); ML_STEP2(B, A, n + 1); }
#undef ML_STEP2
}

__device__ __forceinline__ void mixer_gmlp_item(const Params& p, int l, LAS unsigned char* lds, int item, int tid, int wave, int lane) {
    const int chunk = item >> 2, g = item & 3; const size_t tok0 = (size_t)chunk * 128;
    const bf16* Z = (const bf16*)(p.ws + WS_Z); bf16* BR1 = (bf16*)(p.ws + WS_BR) + (size_t)1 * T * BW;
    const float* ng = p.in[I_GMNG] + l * BW; const float* nb = p.in[I_GMNB] + l * BW;
    const float* wsp = p.in[I_GMWS] + ((size_t)(l * 4 + g) * 128) * 128; const float* bsp = p.in[I_GMBS] + (l * 4 + g) * 128;
    LAS float* vn = (LAS float*)lds;
    for (int r = 0; r < 16; ++r) { const int tk = wave * 16 + r;
        const v4u raw = *(const v4u*)(Z + (tok0 + tk) * ZC + ZC_GMV + 8 * lane); float x[8]; unpack8(raw, x); float s = 0.f;
#pragma unroll
        for (int i = 0; i < 8; ++i) { x[i] = gelu_tanh(x[i]); s += x[i]; }
        const float mean = wave_sum(s) * (1.f / 512.f); float ss = 0.f;
#pragma unroll
        for (int i = 0; i < 8; ++i) { x[i] -= mean; ss += x[i] * x[i]; }
        const float rstd = rsqrtf(wave_sum(ss) * (1.f / 512.f) + LN_EPS);
        if ((lane >> 4) == g) { const int cl = 8 * (lane & 15);
#pragma unroll
            for (int i = 0; i < 8; ++i) vn[tk * 128 + cl + i] = x[i] * rstd * ng[8 * lane + i] + nb[8 * lane + i]; }
    }
    __syncthreads();
    const int t = tid >> 2, cq = tid & 3; float acc[32];
#pragma unroll
    for (int i = 0; i < 32; ++i) acc[i] = 0.f;
    const float* wrow = wsp + (size_t)t * 128;
    for (int s = 0; s <= t; ++s) { const float w = wrow[s]; const LAS float* row = vn + s * 128 + cq * 32;
#pragma unroll
        for (int i4 = 0; i4 < 8; ++i4) { const v4f a = *(const LAS v4f*)(row + 4 * i4); acc[4 * i4] += w * a.x; acc[4 * i4 + 1] += w * a.y; acc[4 * i4 + 2] += w * a.z; acc[4 * i4 + 3] += w * a.w; } }
    const float bias = bsp[t];
#pragma unroll
    for (int i8 = 0; i8 < 4; ++i8) { const v4u raw = *(const v4u*)(Z + (tok0 + t) * ZC + ZC_GMU + g * 128 + cq * 32 + 8 * i8); float u[8]; unpack8(raw, u); float o[8];
#pragma unroll
        for (int i = 0; i < 8; ++i) o[i] = gelu_tanh(u[i]) * (acc[8 * i8 + i] + bias);
        v4u w; w.x = pk2(o[0], o[1]); w.y = pk2(o[2], o[3]); w.z = pk2(o[4], o[5]); w.w = pk2(o[6], o[7]);
        *(v4u*)(BR1 + (tok0 + t) * BW + g * 128 + cq * 32 + 8 * i8) = w; }
    __syncthreads();
}

__device__ __forceinline__ void vt_item(const Params& p, LAS unsigned char* lds, int item, int tid) {
    const int h = item & 3, n = item >> 2; const size_t t0 = (size_t)n * 64;
    const bf16* Z = (const bf16*)(p.ws + WS_Z); bf16* VT = (bf16*)(p.ws + WS_VT);
    LAS unsigned short* vs = (LAS unsigned short*)lds;
#pragma unroll
    for (int r = 0; r < 2; ++r) { const int idx = tid + 512 * r, tk = idx >> 4, c8 = idx & 15;
        *(LAS v4u*)(vs + tk * 136 + 8 * c8) = *(const v4u*)(Z + (t0 + tk) * ZC + ZC_SBV + h * 128 + 8 * c8); }
    __syncthreads();
    { const int d = tid >> 2, jq = tid & 3; unsigned w[8];
#pragma unroll
      for (int x = 0; x < 8; ++x) w[x] = (unsigned)vs[(16 * jq + 2 * x) * 136 + d] | ((unsigned)vs[(16 * jq + 2 * x + 1) * 136 + d] << 16);
      bf16* dst = VT + ((size_t)h * 128 + d) * T + t0 + 16 * jq;
      *(v4u*)dst = (v4u){w[0], w[1], w[2], w[3]}; *(v4u*)(dst + 8) = (v4u){w[4], w[5], w[6], w[7]}; }
    __syncthreads();
}
constexpr int KTP = 136, VTP = 72;
__device__ __forceinline__ void sb_unit(const Params& p, LAS unsigned char* lds, int unit, int tid, int wave, int lane) {
    const int h = unit >> 6, q0 = (unit & 63) * 128, g = lane >> 4, c = lane & 15; const int qrow = q0 + 16 * wave + c;
    const bf16* Z = (const bf16*)(p.ws + WS_Z); const bf16* VT = (const bf16*)(p.ws + WS_VT) + (size_t)h * 128 * T; bf16* BR0 = (bf16*)(p.ws + WS_BR);
    LAS unsigned short* Kt = (LAS unsigned short*)lds;
    LAS unsigned short* Vt = Kt + 2 * 64 * KTP;
    LAS int* flags = (LAS int*)(Vt + 2 * 128 * VTP);
    bf16x8_t qf[4];
#pragma unroll
    for (int ks = 0; ks < 4; ++ks) qf[ks] = *(const bf16x8_t*)(Z + (size_t)qrow * ZC + ZC_SBQ + h * 128 + 32 * ks + 8 * g);
    pg8::f32x4 acc[8];
#pragma unroll
    for (int dt = 0; dt < 8; ++dt) acc[dt] = (pg8::f32x4){0.f, 0.f, 0.f, 0.f};
    float racc = 0.f;
    v4u kr[2], vr[2];
    const int jt = (q0 >> 6) + 1;
#define SB_GLOAD(j_) do { _Pragma("unroll") for (int r = 0; r < 2; ++r) { const int idx = tid + 512 * r; \
        kr[r] = *(const v4u*)(Z + (size_t)(64 * (j_) + (idx >> 4)) * ZC + ZC_SBK + h * 128 + 8 * (idx & 15)); \
        vr[r] = *(const v4u*)(VT + (size_t)(idx >> 3) * T + 64 * (j_) + 8 * (idx & 7)); } } while (0)
#define SB_LWRITE(b_) do { _Pragma("unroll") for (int r = 0; r < 2; ++r) { const int idx = tid + 512 * r; \
        *(LAS v4u*)(Kt + (b_) * 64 * KTP + (idx >> 4) * KTP + 8 * (idx & 15)) = kr[r]; *(LAS v4u*)(Vt + (b_) * 128 * VTP + (idx >> 3) * VTP + 8 * (idx & 7)) = vr[r]; } } while (0)
    LDS_BAR();
    SB_GLOAD(jt); SB_LWRITE(0);
    LDS_BAR();
    for (int j = jt, it = 0; j >= 0; --j, ++it) {
        const int cur = it & 1;
        SB_GLOAD(j > 0 ? j - 1 : 0);
        const bool wdone = __all(racc > 104.f);
        if (64 * j < q0 + 16 * wave + 15 && !wdone) {
            const LAS unsigned short* Kc = Kt + cur * 64 * KTP; const LAS unsigned short* Vc = Vt + cur * 128 * VTP;
            pg8::f32x4 z[4];
#pragma unroll
            for (int s = 0; s < 4; ++s) { z[s] = (pg8::f32x4){0.f, 0.f, 0.f, 0.f};
#pragma unroll
                for (int ks = 0; ks < 4; ++ks) z[s] = __builtin_amdgcn_mfma_f32_16x16x32_bf16(*(const LAS bf16x8_t*)(Kc + (16 * s + c) * KTP + 32 * ks + 8 * g), qf[ks], z[s], 0, 0, 0); }
            float sp[4][4], t[4], xs[4]; bool mk[4][4];
#pragma unroll
            for (int s = 0; s < 4; ++s) { t[s] = 0.f;
#pragma unroll
                for (int r = 0; r < 4; ++r) { const int key = 64 * j + 16 * s + 4 * g + r; mk[s][r] = key < qrow; const float zz = z[s][r] * 0.08838834764831845f; z[s][r] = zz;
                    sp[s][r] = mk[s][r] ? softplusf_(zz) : 0.f; t[s] += sp[s][r]; } }
            float grand = 0.f, higher[4];
#pragma unroll
            for (int s = 3; s >= 0; --s) { float x = t[s]; float y = __shfl(x, lane + 16); x += (g < 3) ? y : 0.f; y = __shfl(x, lane + 32); x += (g < 2) ? y : 0.f;
                xs[s] = x - t[s];
                const float tot = __shfl(x, c); higher[s] = grand; grand += tot; }
            bf16x8_t pf[2];
#pragma unroll
            for (int s = 0; s < 4; ++s) { float a[4]; float e = 0.f;
#pragma unroll
                for (int r = 3; r >= 0; --r) { const float la = z[s][r] - sp[s][r] - (racc + higher[s] + xs[s] + e); a[r] = mk[s][r] ? __expf(la) : 0.f; e += sp[s][r]; }
                const unsigned w0 = pk2(a[0], a[1]), w1 = pk2(a[2], a[3]);
                if ((s & 1) == 0) { pf[s >> 1][0] = (short)(w0 & 0xffff); pf[s >> 1][1] = (short)(w0 >> 16); pf[s >> 1][2] = (short)(w1 & 0xffff); pf[s >> 1][3] = (short)(w1 >> 16); }
                else              { pf[s >> 1][4] = (short)(w0 & 0xffff); pf[s >> 1][5] = (short)(w0 >> 16); pf[s >> 1][6] = (short)(w1 & 0xffff); pf[s >> 1][7] = (short)(w1 >> 16); } }
            racc += grand;
#pragma unroll
            for (int dt = 0; dt < 8; ++dt)
#pragma unroll
                for (int k2 = 0; k2 < 2; ++k2) { const v2u lo = *(const LAS v2u*)(Vc + (16 * dt + c) * VTP + 32 * k2 + 4 * g), hi = *(const LAS v2u*)(Vc + (16 * dt + c) * VTP + 32 * k2 + 16 + 4 * g);
                    const v4u vv = (v4u){lo.x, lo.y, hi.x, hi.y};
                    acc[dt] = __builtin_amdgcn_mfma_f32_16x16x32_bf16(__builtin_bit_cast(bf16x8_t, vv), pf[k2], acc[dt], 0, 0, 0); }
        }
        const bool wd2 = __all(racc > 104.f);
        if (lane == 0) flags[cur * 8 + wave] = wd2 ? 1 : 0;
        SB_LWRITE(cur ^ 1);
        LDS_BAR();
        int alld = 1;
#pragma unroll
        for (int w = 0; w < 8; ++w) alld &= flags[cur * 8 + w];
        if (alld) break;
    }
#undef SB_GLOAD
#undef SB_LWRITE
#pragma unroll
    for (int dt = 0; dt < 8; ++dt) { v2u w; w.x = pk2(acc[dt][0], acc[dt][1]); w.y = pk2(acc[dt][2], acc[dt][3]); *(v2u*)(BR0 + (size_t)qrow * BW + h * 128 + 16 * dt + 4 * g) = w; }
}

__device__ __forceinline__ void phase_mixers(const Params& p, int l, LAS unsigned char* lds, int wg, int G, int tid, int wave, int lane, const XcdBarrier& bar) {
#if defined(PROBE_SPLIT)
    if (wg < 16) gdn_seq2(p, lds, wg, tid, wave, lane); else if (wg < 36) ml_seq2(p, lds, wg - 16, tid, wave, lane);
    xcd_barrier(bar);
    const int w2 = wg, G2 = G;
#else
    if (wg < 16) { gdn_seq2(p, lds, wg, tid, wave, lane); return; }
    if (wg < 36) { ml_seq2(p, lds, wg - 16, tid, wave, lane); return; }
    const int w2 = wg - 36, G2 = G - 36;
#endif
    for (int it = w2; it < 256; it += G2) mixer_gmlp_item(p, l, lds, it, tid, wave, lane);
    for (int it = w2; it < 256; it += G2) sb_unit(p, lds, it, tid, wave, lane);
#if !defined(PROBE_CONV0)
    __syncthreads();
    phase_convert<1>(p, l, lds, w2 * 8 + wave, G2 * 8, wave, lane);
#endif
}

__device__ __forceinline__ void phase_post(const Params& p, int l, int gw, int NGW, int lane) {
    const bf16* Z = (const bf16*)(p.ws + WS_Z); const float* GO = (const float*)(p.ws + WS_GO); const float* HO = (const float*)(p.ws + WS_HO); const float* HDEN = (const float*)(p.ws + WS_HDEN);
    bf16* BR2 = (bf16*)(p.ws + WS_BR) + (size_t)2 * T * BW; bf16* BR3 = (bf16*)(p.ws + WS_BR) + (size_t)3 * T * BW;
    const float* gng = p.in[I_GDNNG] + l * 128; const float* mng = p.in[I_MLNG] + l * BW;
    for (int t = gw; t < T; t += NGW) {
        {   const v4f a0 = *(const v4f*)(GO + (size_t)t * BW + 8 * lane), a1 = *(const v4f*)(GO + (size_t)t * BW + 8 * lane + 4); float o[8] = {a0.x, a0.y, a0.z, a0.w, a1.x, a1.y, a1.z, a1.w}; float ss = 0.f;
#pragma unroll
            for (int i = 0; i < 8; ++i) ss += o[i] * o[i];
            const float r = rsqrtf(sum16(ss) * (1.f / 128.f) + LN_EPS);
            const v4u graw = *(const v4u*)(Z + (size_t)t * ZC + ZC_GDNG + 8 * lane); float gt[8]; unpack8(graw, gt);
#pragma unroll
            for (int i = 0; i < 8; ++i) o[i] = o[i] * r * gng[(8 * lane + i) & 127] * siluf_(gt[i]);
            v4u w; w.x = pk2(o[0], o[1]); w.y = pk2(o[2], o[3]); w.z = pk2(o[4], o[5]); w.w = pk2(o[6], o[7]); *(v4u*)(BR2 + (size_t)t * BW + 8 * lane) = w; }
        {   const v4f a0 = *(const v4f*)(HO + (size_t)t * BW + 8 * lane), a1 = *(const v4f*)(HO + (size_t)t * BW + 8 * lane + 4); float o[8] = {a0.x, a0.y, a0.z, a0.w, a1.x, a1.y, a1.z, a1.w}; float ss = 0.f;
            const float dn = 1.f / fmaxf(fabsf(HDEN[(size_t)t * 4 + (lane >> 4)]), 1.f);
#pragma unroll
            for (int i = 0; i < 8; ++i) { o[i] *= dn; ss += o[i] * o[i]; }
            const float r = rsqrtf(sum16(ss) * (1.f / 128.f) + LN_EPS);
            const v4u graw = *(const v4u*)(Z + (size_t)t * ZC + ZC_MLO + 8 * lane); float gt[8]; unpack8(graw, gt);
#pragma unroll
            for (int i = 0; i < 8; ++i) o[i] = o[i] * r * mng[8 * lane + i] * sigmoidf_(gt[i]);
            v4u w; w.x = pk2(o[0], o[1]); w.y = pk2(o[2], o[3]); w.z = pk2(o[4], o[5]); w.w = pk2(o[6], o[7]); *(v4u*)(BR3 + (size_t)t * BW + 8 * lane) = w; }
    }
}

__device__ __forceinline__ void ln_row(const float* yrow, const float* g, const float* b, int lane, v4f (&v)[8]) {
    const v4f* yr = (const v4f*)yrow + lane; float s = 0.f;
#pragma unroll
    for (int j = 0; j < 8; ++j) { v[j] = yr[64 * j]; s += (v[j].x + v[j].y) + (v[j].z + v[j].w); }
    const float mean = wave_sum(s) * (1.f / D); float s2 = 0.f;
#pragma unroll
    for (int j = 0; j < 8; ++j) { v[j] = v[j] - mean; s2 += (v[j].x * v[j].x + v[j].y * v[j].y) + (v[j].z * v[j].z + v[j].w * v[j].w); }
    const float rstd = rsqrtf(wave_sum(s2) * (1.f / D) + LN_EPS);
#pragma unroll
    for (int j = 0; j < 8; ++j) { const v4f gg = ((const v4f*)g)[lane + 64 * j], bb = ((const v4f*)b)[lane + 64 * j]; v[j] = v[j] * rstd * gg + bb; }
}
__device__ __forceinline__ void phase_ln1_router(const Params& p, int l, LAS unsigned char* lds, int wg, int G, int wave, int lane, int cnt_shift = 0) {
    const float* Y = (const float*)(p.ws + WS_Y); float* X1 = (float*)(p.ws + WS_X1); bf16* X1B = (bf16*)(p.ws + WS_X1B); int* LIST = (int*)(p.ws + WS_LIST); float* WL = (float*)(p.ws + WS_WL); unsigned* SLOT = (unsigned*)(p.ws + WS_SLOT);
    unsigned* cnt = (unsigned*)(p.ws + WS_CTL) + CW_CNT + l * 4096 + cnt_shift;
    const float* g1 = p.in[I_LN1G] + (size_t)l * D; const float* b1 = p.in[I_LN1B] + (size_t)l * D;
    const float* wr = p.in[I_WR] + (size_t)l * D * NE; const float rbias = p.in[I_RB][l * NE + lane];
    LAS float* xt = (LAS float*)lds;
    LAS float* part = (LAS float*)(lds + 65536);
    LAS unsigned* selm = (LAS unsigned*)(lds + 65536 + 16384);
    LAS float* wtm = (LAS float*)(lds + 65536 + 16384 + 16640);
    LAS unsigned char* rkm = (LAS unsigned char*)(lds + 65536 + 16384 + 16640 + 16384);
    for (int tl = wg; tl < T / 8; tl += G) {
        const size_t m = (size_t)tl * 8 + wave;
        {   v4f v[8]; ln_row(Y + m * D, g1, b1, lane, v);
            v4f* xo = (v4f*)(X1 + m * D) + lane; v2u* xb = (v2u*)(X1B + m * D) + lane;
#pragma unroll
            for (int j = 0; j < 8; ++j) { xo[64 * j] = v[j];
#if MOE_UP_FP8
                { unsigned w = 0; w = __builtin_amdgcn_cvt_pk_fp8_f32(v[j].x, v[j].y, w, false); w = __builtin_amdgcn_cvt_pk_fp8_f32(v[j].z, v[j].w, w, true); ((unsigned*)((unsigned char*)X1B + m * D))[lane + 64 * j] = w; }
#else
                { v2u o; o.x = pk2(v[j].x, v[j].y); o.y = pk2(v[j].z, v[j].w); xb[64 * j] = o; }
#endif
                *(LAS v4f*)(xt + wave * D + 4 * lane + 256 * j) = v[j]; } }
        __syncthreads();
        {   float acc[8];
#pragma unroll
            for (int r = 0; r < 8; ++r) acc[r] = 0.f;
#pragma unroll 8
            for (int d4 = 0; d4 < 64; ++d4) { const int d = wave * 256 + 4 * d4;
                const float w0 = wr[(size_t)(d + 0) * NE + lane], w1 = wr[(size_t)(d + 1) * NE + lane], w2 = wr[(size_t)(d + 2) * NE + lane], w3 = wr[(size_t)(d + 3) * NE + lane];
#pragma unroll
                for (int r = 0; r < 8; ++r) { const v4f xv = *(const LAS v4f*)(xt + r * D + d); acc[r] += xv.x * w0 + xv.y * w1 + xv.z * w2 + xv.w * w3; } }
#pragma unroll
            for (int r = 0; r < 8; ++r) part[(wave * 8 + r) * 64 + lane] = acc[r]; }
        __syncthreads();
        {   float logit = 0.f;
#pragma unroll
            for (int w = 0; w < 8; ++w) logit += part[(w * 8 + wave) * 64 + lane];
            const float s = sigmoidf_(logit), biased = s + rbias;
            const float m1 = max8(biased); const float li = (float)(lane & 7);
            const float first = min8(biased == m1 ? li : 8.f);
            const float m2 = max8(li == first ? -INFINITY : biased);
            const float gs = m1 + m2; const int myg = lane >> 3; int grank = 0;
#pragma unroll
            for (int g2 = 0; g2 < 8; ++g2) { const float o = __builtin_bit_cast(float, __builtin_amdgcn_readlane(__builtin_bit_cast(int, gs), g2 * 8)); grank += (o > gs || (o == gs && g2 < myg)) ? 1 : 0; }
            const float masked = grank < 4 ? biased : -INFINITY; int rank = 0;
#pragma unroll
            for (int e2 = 0; e2 < 64; ++e2) { const float o = __builtin_bit_cast(float, __builtin_amdgcn_readlane(__builtin_bit_cast(int, masked), e2)); rank += (o > masked || (o == masked && e2 < lane)) ? 1 : 0; }
            const float wsel = rank < 6 ? s : 0.f; const float tot = wave_sum(wsel);
            const int ri = ((tl - wg) / G) * 8 + wave;
            selm[ri * 64 + lane] = (rank < 6) ? 1u : 0u; rkm[ri * 64 + lane] = (unsigned char)rank; wtm[ri * 64 + lane] = wsel / tot * 2.5f; }
        __syncthreads();
    }
    const int nrows = ((T / 8 - wg + G - 1) / G) * 8;
    if (wave == 0) { unsigned n = 0;
        for (int r = 0; r < nrows; ++r) n += selm[r * 64 + lane];
        unsigned base = 0; if (n && !(PROBE_NOATOM && cnt_shift)) base = __hip_atomic_fetch_add(cnt + 64 * lane, n, __ATOMIC_RELAXED, __HIP_MEMORY_SCOPE_AGENT);
        selm[64 * 64 + lane] = base; }
    __syncthreads();
    for (int ri = wave; ri < nrows; ri += 8) { unsigned pos = selm[64 * 64 + lane];
        for (int r = 0; r < ri; ++r) pos += selm[r * 64 + lane];
        if (selm[ri * 64 + lane]) { const size_t m = (size_t)(wg + (ri >> 3) * G) * 8 + (ri & 7); const int rk = rkm[ri * 64 + lane];
            LIST[lane * T + pos] = (int)m; WL[lane * T + pos] = wtm[ri * 64 + lane]; SLOT[m * 8 + rk] = ((unsigned)lane << 16) | pos; } }
    __syncthreads();
}
__device__ __forceinline__ void phase_combine_ln2(const Params& p, int l, float* dst, int gw, int NGW, int lane) {
    const float* X1 = (const float*)(p.ws + WS_X1); const bf16* YE = (const bf16*)(p.ws + WS_YEXP); const unsigned* SLOT = (const unsigned*)(p.ws + WS_SLOT);
    const unsigned* cnt = (const unsigned*)(p.ws + WS_CTL) + CW_CNT + l * 4096;
    const float* g2 = p.in[I_LN2G] + (size_t)l * D; const float* b2 = p.in[I_LN2B] + (size_t)l * D;
    const int tiles = ((int)cnt[64 * lane] + 255) >> 8; const float incl = wave_scan_incl((float)tiles);
    const int toff = (int)incl - tiles;
    const int tsh = __builtin_amdgcn_readlane((int)incl, 63);
    for (int m = gw; m < T; m += NGW) {
        v4f v[8]; const v4f* xr = (const v4f*)(X1 + (size_t)m * D) + lane;
#pragma unroll
        for (int j = 0; j < 8; ++j) v[j] = xr[64 * j] * ALPHA;
#pragma unroll
        for (int k = 0; k < 7; ++k) { size_t row;
            if (k == 0) row = (size_t)tsh * 256 + m;
            else { const unsigned s = __builtin_amdgcn_readfirstlane(SLOT[(size_t)m * 8 + (k - 1)]); const int e = (int)(s >> 16); row = (size_t)__builtin_amdgcn_readlane(toff, e) * 256 + (s & 0xffffu); }
            const v2u* yr = (const v2u*)(YE + row * D) + lane;
#pragma unroll
            for (int j = 0; j < 8; ++j) { const v2u y = yr[64 * j]; v[j].x += bflo(y.x); v[j].y += bfhi(y.x); v[j].z += bflo(y.y); v[j].w += bfhi(y.y); } }
        float s = 0.f;
#pragma unroll
        for (int j = 0; j < 8; ++j) s += (v[j].x + v[j].y) + (v[j].z + v[j].w);
        const float mean = wave_sum(s) * (1.f / D); float s2 = 0.f;
#pragma unroll
        for (int j = 0; j < 8; ++j) { v[j] = v[j] - mean; s2 += (v[j].x * v[j].x + v[j].y * v[j].y) + (v[j].z * v[j].z + v[j].w * v[j].w); }
        const float rstd = rsqrtf(wave_sum(s2) * (1.f / D) + LN_EPS);
        v4f* xo = (v4f*)(dst + (size_t)m * D) + lane;
#pragma unroll
        for (int j = 0; j < 8; ++j) { const v4f gg = ((const v4f*)g2)[lane + 64 * j], bb = ((const v4f*)b2)[lane + 64 * j]; xo[64 * j] = v[j] * rstd * gg + bb; }
    }
}

constexpr int NPH = 11;
template <class S> struct DupOrder {
    S s; int n;
    __device__ __forceinline__ bool next(int i, Unit& u) const { return s.next(i >= n ? i - n : i, u); }
    __device__ __forceinline__ int row_token(int i, int r) const { return s.row_token(i >= n ? i - n : i, r); }
    __device__ __forceinline__ void a_ready(const Unit& u) const { s.a_ready(u); }
    __device__ __forceinline__ void done(const Unit& u) const { s.done(u); }
};
template <class S> __device__ __forceinline__ int count_units(const S& s) { Unit u; int n = 0; while (n < 64 && s.next(n, u)) ++n; return n; }
#define ORDER_T(k, T) typename std::conditional<PROBE_DUP == (k), DupOrder<T>, T>::type
template <class S> __device__ __forceinline__ DupOrder<S> make_order(const S& s, std::true_type) { DupOrder<S> d{s, count_units(s)}; d.n = count_units(s); return d; }
template <class S> __device__ __forceinline__ S make_order(const S& s, std::false_type) { return s; }
#define MAKE_ORDER(k, s) make_order(s, std::integral_constant<bool, PROBE_DUP == (k)>())
template <int l>
__device__ __forceinline__ void run_layer(const Params& p, LAS unsigned char* lds, const XcdBarrier& bar, int tid, int lane, int wave, int G, int wg, int gw, int NGW) {
    unsigned char* ws = p.ws;
    {
        const float* xin = (l == 0) ? p.in[I_X] : (const float*)(ws + WS_XCUR);
        float* xout = (l == NL - 1) ? p.out : (float*)(ws + WS_XCUR);
#ifndef PROBE_DUP
#define PROBE_DUP (-1)
#endif
#define IS_GEMM_PH(k) ((k) == 1 || (k) == 5 || (k) == 6 || (k) == 8 || (k) == 9)
#define REP(k) _Pragma("nounroll") for (int _r = 0; _r < ((PROBE_DUP == (k) && !IS_GEMM_PH(k)) ? 2 + (p.ph_lo >> 20) : 1); ++_r)
#ifndef PH_MASK
#define PH_MASK 0x7ff
#endif
#define RUN(k) (((PH_MASK >> (k)) & 1) && p.ph_lo <= l * NPH + (k) && l * NPH + (k) < p.ph_hi)
#define SEAM(k) do { if (l * NPH + (k) + 1 < p.ph_hi) xcd_barrier(bar); } while (0)
        if (RUN(0)) { REP(0) { phase_convert<0>(p, l, lds, gw, NGW, wave, lane);
#if defined(PROBE_CONV0)
            phase_convert<1>(p, l, lds, gw, NGW, wave, lane);
#endif
 phase_xprep(p, l, xin, lds, gw, NGW, tid, lane); } SEAM(0); }
        if (RUN(1)) { REP(1) { pg8::Gemm g{(const bf16*)(ws + WS_XB), (const bf16*)(ws + WS_WIN), T, ZC, D / 2, D / 2, D / 2}; pg8::StaticOrder S; S.init(T, ZC, G, wg);
            pg8::EpiBf16<0> E{(bf16*)(ws + WS_Z), ZC, nullptr, 0, 0, 1.f / 64.f};
            auto S2 = MAKE_ORDER(1, S); pg8::gemm_phase<pg8::EpiBf16<0>, ORDER_T(1, pg8::StaticOrder), true, true, true>(lds, g, S2, E); } SEAM(1); }
        if (RUN(2)) { REP(2) { for (int it = wg; it < 1536; it += G) { if (it < 512) gdn_pre_item(p, l, lds, it, tid, wave, lane); else if (it < 1024) ml_pre_item(p, l, lds, it - 512, tid, wave, lane); else vt_item(p, lds, it - 1024, tid); } } SEAM(2); }
        if (RUN(3)) { REP(3) { phase_mixers(p, l, lds, wg, G, tid, wave, lane, bar); } SEAM(3); }
        if (RUN(4)) { REP(4) { phase_post(p, l, gw, NGW, lane); } SEAM(4); }
        if (RUN(5)) { REP(5) { pg8::Gemm g{(const bf16*)(ws + WS_BR), (const bf16*)(ws + WS_WBR), 4 * T, 4 * D, BW, BW, BW}; MergeOrder S{G, wg};
            EpiMerge E{(const bf16*)(ws + WS_Z), (float*)(ws + WS_MTMP), (bf16*)(ws + WS_MSUM)};
            auto S2 = MAKE_ORDER(5, S); pg8::gemm_phase<EpiMerge, ORDER_T(5, MergeOrder), true, true>(lds, g, S2, E); } SEAM(5); }
        if (RUN(6)) { REP(6) { pg8::Gemm g{(const bf16*)(ws + WS_MSUM), (const bf16*)(ws + WS_WOUT), T, D, D, D, D}; pg8::StaticOrder S; S.init(T, D, G, wg);
            EpiResid E{xin, (float*)(ws + WS_Y)};
            auto S2 = MAKE_ORDER(6, S); pg8::gemm_phase<EpiResid, ORDER_T(6, pg8::StaticOrder), true, true>(lds, g, S2, E); } SEAM(6); }
        if (RUN(7)) { REP(7) { phase_ln1_router(p, l, lds, wg, G, wave, lane, (PROBE_DUP == 7 && _r == 0) ? 16384 : 0); } SEAM(7); }
        if (RUN(8)) { REP(8) { const unsigned* cnt = (const unsigned*)(ws + WS_CTL) + CW_CNT + l * 4096; MoeTab M(lds); moe_tables(M, cnt, tid, lane, wave);
            UpOrder S{M, 0}; S.n = up_order_build(M, (const int*)(ws + WS_LIST), (const float*)(ws + WS_WL), wg, G, tid);
            constexpr int KU = MOE_UP_FP8 ? D / 2 : D;
            pg8::Gemm g{(const bf16*)(ws + WS_X1B), (const bf16*)(ws + WS_WUP), T, NEX * 1024, KU, KU, KU};
            EpiGluSparse E{(LAS const float*)M.wt, (bf16*)(ws + WS_HB)};
            auto S2 = MAKE_ORDER(8, S); pg8::gemm_phase_gather<EpiGluSparse, ORDER_T(8, UpOrder), MOE_UP_FP8 != 0>(lds, g, S2, E); } SEAM(8); }
        if (RUN(9)) { REP(9) { const unsigned* cnt = (const unsigned*)(ws + WS_CTL) + CW_CNT + l * 4096; MoeTab M(lds); moe_tables(M, cnt, tid, lane, wave);
            DownOrder S{M, G, wg, 8 * M.t[65]};
            pg8::Gemm g{(const bf16*)(ws + WS_HB), (const bf16*)(ws + WS_WDN), HROWS, NEX * D, ED, ED, ED};
            EpiYexp E{(bf16*)(ws + WS_YEXP)};
            auto S2 = MAKE_ORDER(9, S); pg8::gemm_phase<EpiYexp, ORDER_T(9, DownOrder), true, true>(lds, g, S2, E); } SEAM(9); }
        if (RUN(10)) { REP(10) { phase_combine_ln2(p, l, xout, gw, NGW, lane); } SEAM(10); }
#undef RUN
#undef SEAM
    }
}
__global__ void __launch_bounds__(512, 2) fwd_kernel(Params p) {
    extern __shared__ __attribute__((aligned(16))) unsigned char lds_raw[];
    LAS unsigned char* lds = (LAS unsigned char*)lds_raw;
    const int tid = threadIdx.x, lane = tid & 63, wave = __builtin_amdgcn_readfirstlane(tid >> 6);
    const int G = gridDim.x, wg = blockIdx.x, gw = wg * 8 + wave, NGW = G * 8;
    volatile LAS unsigned* MISC = (volatile LAS unsigned*)(lds + MISC_OFF);
    if (tid < 32) MISC[tid] = 0u;
    __syncthreads();
    unsigned* ctl = (unsigned*)(p.ws + WS_CTL);
    const bool multi = (p.ph_hi - p.ph_lo) > 1;
    XcdBarrier bar; bar.bar = ctl + CW_BAR; bar.x = 0; bar.st = nullptr;
    if (multi) bar = xcd_barrier_post(ctl + CW_BAR, MISC + 8);
    run_layer<0>(p, lds, bar, tid, lane, wave, G, wg, gw, NGW);
    run_layer<1>(p, lds, bar, tid, lane, wave, G, wg, gw, NGW);
}

#ifndef MK_MULTI_LAUNCH
#define MK_MULTI_LAUNCH 0
#endif
extern "C" void kernel_launch(void* const* d_in, const int* in_sizes, int n_in, void* d_out, int out_size, void* d_ws, size_t ws_size, hipStream_t stream) {
    static int grid = 0;
    if (grid == 0) {
        if (n_in != 27 || out_size != T * D || ws_size < WS_END) { fprintf(stderr, "kernel_launch: unexpected shapes (n_in %d out %d ws %zu need %zu)\n", n_in, out_size, ws_size, (size_t)WS_END); grid = -1; return; }
        int dev = 0, cus = 0, per_cu = 0;
        if (hipGetDevice(&dev) != hipSuccess || hipDeviceGetAttribute(&cus, hipDeviceAttributeMultiprocessorCount, dev) != hipSuccess) { grid = -1; return; }
        if (hipFuncSetAttribute((const void*)fwd_kernel, hipFuncAttributeMaxDynamicSharedMemorySize, LDS_BYTES) != hipSuccess) { fprintf(stderr, "kernel_launch: hipFuncSetAttribute failed\n"); grid = -1; return; }
        if (hipOccupancyMaxActiveBlocksPerMultiprocessor(&per_cu, (const void*)fwd_kernel, 512, LDS_BYTES) != hipSuccess || per_cu < 1) { fprintf(stderr, "kernel_launch: occupancy query says %d\n", per_cu); }
        (void)hipGetLastError();
        grid = cus;
    }
    if (grid < 0) return;
    (void)hipMemsetAsync((char*)d_ws + WS_CTL, 0, CTL_ZERO_BYTES, stream);
    Params p{};
    for (int i = 0; i < 27; ++i) p.in[i] = (const float*)d_in[i];
    p.out = (float*)d_out; p.ws = (unsigned char*)d_ws;
#if MK_MULTI_LAUNCH
    for (int ph = 0; ph < NL * NPH; ++ph) { p.ph_lo = ph; p.ph_hi = ph + 1; hipLaunchKernelGGL(fwd_kernel, dim3(grid), dim3(512), LDS_BYTES, stream, p); }
#else
    p.ph_lo = 0; p.ph_hi = NL * NPH; hipLaunchKernelGGL(fwd_kernel, dim3(grid), dim3(512), LDS_BYTES, stream, p);
#endif
}
```

```cpp
#include <hip/hip_runtime.h>
#include <cstdio>
#include <cstdint>
#include <type_traits>
namespace pg8 {
#define PG8_LAS __attribute__((address_space(3)))
typedef unsigned short bf16_t;
typedef short bf16x8 __attribute__((ext_vector_type(8)));
typedef float f32x4 __attribute__((ext_vector_type(4)));
typedef unsigned u32x4 __attribute__((ext_vector_type(4)));
constexpr int BM = 256, BK = 64, HALF = 128, HTB = HALF * BK * 2  , STAGE_BYTES = 8 * HTB, NXCD = 8, WGM = 8;

__host__ __device__ __forceinline__ int lds_byte(int r, int c) { const int st = (r >> 4) * 2 + (c >> 5), rr = r & 15, cc = c & 31, ob = rr * 64 + cc * 2; return st * 1024 + (ob ^ (((ob >> 9) & 1) << 5)); }
__host__ __device__ __forceinline__ void stage_rc(int b, int& R, int& C) { const int st = b / 1024, sb = b % 1024, swz = sb ^ (((sb >> 9) & 1) << 5); R = (st >> 1) * 16 + swz / 64; C = (st & 1) * 32 + (swz % 64) / 2; }
__host__ __device__ __forceinline__ int perm32(int rho) { const int n = rho >> 4, i = rho & 15; return 8 * (i >> 2) + 4 * n + (i & 3); }

struct Unit { int pm, pn, aux; };
struct Gemm { const bf16_t* A; const bf16_t* Bt; int M, N, K, lda, ldb; };

struct StaticOrder {
    int nM, nN, nwg, G, c;
    __host__ __device__ void init(int M, int N, int G_, int c_) { nM = M / BM; nN = N / BM; nwg = nM * nN; G = G_; c = c_; }
    __host__ __device__ bool next(int i, Unit& u) const {
        const long L = (long)i * G + c; if (L >= nwg) return false;
        int wgid = (int)L; { const int q = nwg / NXCD, r = nwg % NXCD, xcd = wgid % NXCD, off = wgid / NXCD; wgid = (xcd < r ? xcd * (q + 1) : r * (q + 1) + (xcd - r) * q) + off; }
        const int nig = WGM * nN, gid = wgid / nig, fm = gid * WGM, gsz = (nM - fm) < WGM ? (nM - fm) : WGM;
        u.pm = fm + ((wgid % nig) % gsz); u.pn = (wgid % nig) / gsz; return true;
    }
    __device__ __forceinline__ void a_ready(const Unit&) const {}
    __device__ __forceinline__ void done(const Unit&) const {}
};

__device__ __forceinline__ unsigned cvt_pk_bf16(float lo, float hi) { unsigned r; asm volatile("v_cvt_pk_bf16_f32 %0, %1, %2" : "=v"(r) : "v"(lo), "v"(hi)); return r; }
typedef float f32x2 __attribute__((ext_vector_type(2)));
__device__ __forceinline__ f32x2 gelu_pk(f32x2 v) {
    const f32x2 av = __builtin_elementwise_abs(v), d = av * 0.2316418882f + 1.0f;
    f32x2 t; t.x = __builtin_amdgcn_rcpf(d.x); t.y = __builtin_amdgcn_rcpf(d.y);
    f32x2 q = t * 0.5307027145f + (-0.7265760135f); q = q * t + 0.7107068705f; q = q * t + (-0.142248368f); q = q * t + 0.127414796f; q = q * t;
    const f32x2 s = (v * v) * (-0.72134752044f);
    f32x2 e; e.x = __builtin_amdgcn_exp2f(s.x); e.y = __builtin_amdgcn_exp2f(s.y);
    const f32x2 m = v * (q * e), r = v - m;
    f32x2 o; o.x = v.x < 0.f ? m.x : r.x; o.y = v.y < 0.f ? m.y : r.y; return o;
}

template <int ACT  > struct EpiBf16 {
    static constexpr bool PERM = true, AFTER_DRAIN = false; static_assert(ACT == 0 || ACT == 1, "EpiBf16: ACT is 0 (none) or 1 (gelu_pk)");
    bf16_t* O; int ldc; const float* bias; int split_cols; size_t split_stride; float scale0;
    __device__ __forceinline__ void operator()(const f32x4 (&acc)[2][2][4][2], const Unit& u, int wr, int wc, int fr, int fq) const {
        const int row0 = u.pm * BM + wr * 64 + fr; int colt = u.pn * BM; bf16_t* base = O;
        float sc = scale0; if (split_cols) { const int t = colt / split_cols; base += (size_t)t * split_stride; colt -= t * split_cols; if (t != 0) sc = 1.f; }
        const int col0 = colt + wc * 32 + 8 * fq, bcol0 = u.pn * BM + wc * 32 + 8 * fq;
        f32x4 bv[2][2];
#pragma unroll
        for (int bj = 0; bj < 2; ++bj)
#pragma unroll
            for (int n = 0; n < 2; ++n) bv[bj][n] = bias ? *(const f32x4*)(bias + bcol0 + bj * HALF + 4 * n) : (f32x4){0.f, 0.f, 0.f, 0.f};
#pragma unroll
        for (int ai = 0; ai < 2; ++ai)
#pragma unroll
            for (int m = 0; m < 4; ++m) { bf16_t* rowp = base + (size_t)(row0 + ai * HALF + m * 16) * ldc + col0;
#pragma unroll
                for (int bj = 0; bj < 2; ++bj) { f32x4 v0 = acc[ai][bj][m][0] + bv[bj][0], v1 = acc[ai][bj][m][1] + bv[bj][1];
                    if (ACT == 1) { f32x2 a = gelu_pk((f32x2){v0[0], v0[1]}), b = gelu_pk((f32x2){v0[2], v0[3]}), c = gelu_pk((f32x2){v1[0], v1[1]}), d = gelu_pk((f32x2){v1[2], v1[3]});
                        v0 = (f32x4){a.x, a.y, b.x, b.y}; v1 = (f32x4){c.x, c.y, d.x, d.y}; }
                    v0 = v0 * sc; v1 = v1 * sc; u32x4 w; w.x = cvt_pk_bf16(v0[0], v0[1]); w.y = cvt_pk_bf16(v0[2], v0[3]); w.z = cvt_pk_bf16(v1[0], v1[1]); w.w = cvt_pk_bf16(v1[2], v1[3]);
                    *(u32x4*)(rowp + bj * HALF) = w; } }
    }
};

typedef int i32x8 __attribute__((ext_vector_type(8)));
__device__ __forceinline__ i32x8 cat8(const bf16x8 a, const bf16x8 b) { typedef int i32x4 __attribute__((ext_vector_type(4))); const i32x4 x = __builtin_bit_cast(i32x4, a), y = __builtin_bit_cast(i32x4, b); return (i32x8){x[0], x[1], x[2], x[3], y[0], y[1], y[2], y[3]}; }
__device__ __forceinline__ bf16x8 lo8(const i32x8 v) { typedef int i32x4 __attribute__((ext_vector_type(4))); return __builtin_bit_cast(bf16x8, __builtin_shufflevector(v, v, 0, 1, 2, 3)); }
__device__ __forceinline__ bf16x8 hi8(const i32x8 v) { typedef int i32x4 __attribute__((ext_vector_type(4))); return __builtin_bit_cast(bf16x8, __builtin_shufflevector(v, v, 4, 5, 6, 7)); }
template <class Epi, class Sched, bool ALIGN_EPI = false, bool SP2 = false, bool FP8 = false>
__device__ __forceinline__ void gemm_phase(PG8_LAS unsigned char* lds, const Gemm g, const Sched& S, const Epi& E) {
    const int tid = threadIdx.x, wid = __builtin_amdgcn_readfirstlane(tid >> 6), lane = tid & 63, wr = wid >> 2, wc = wid & 3, fr = lane & 15, fq = lane >> 4;
    const int K = g.K, nt = K / BK;
    unsigned voffA[2], voffB[2];
#pragma unroll
    for (int i = 0; i < 2; ++i) { int R, C; stage_rc(tid * 16 + i * 8192, R, C); const int Rb = Epi::PERM ? ((R & ~31) + perm32(R & 31)) : R;
        voffA[i] = (unsigned)(R * g.lda + C) * 2u; voffB[i] = (unsigned)(Rb * g.ldb + C) * 2u; }
    const size_t kstep = (size_t)(BK * 2);
    const size_t hstepA = (size_t)HALF * g.lda * 2, hstepB = (size_t)HALF * g.ldb * 2;
    const size_t tstepA = 2 * hstepA, tstepB = 2 * hstepB;
    const unsigned ldsw = (unsigned)wid * 1024u;
    const int aoff = lds_byte(wr * 64 + fr, fq * 8), boff = lds_byte(wc * 32 + fr, fq * 8);
#define PG8_SA(b, h) (((b) * 2 + (h)) * HTB)
#define PG8_SB(b, h) ((4 + (b) * 2 + (h)) * HTB)
#define PG8_STAGE(bufoff, gbase, voff) do { _Pragma("unroll") for (int _i = 0; _i < 2; ++_i) \
        __builtin_amdgcn_global_load_lds((const unsigned*)((const char*)(gbase) + (voff)[_i]), (PG8_LAS unsigned*)(lds + (bufoff) + ldsw + _i * 8192), 16, 0, 0); } while (0)
#define PG8_LDA(dst, b, h) do { _Pragma("unroll") for (int m = 0; m < 4; ++m) { if constexpr (FP8) dst##8[m] = cat8(*(const PG8_LAS bf16x8*)(lds + PG8_SA(b, h) + aoff + m * 2048), *(const PG8_LAS bf16x8*)(lds + PG8_SA(b, h) + aoff + m * 2048 + 1024)); \
        else { _Pragma("unroll") for (int k = 0; k < 2; ++k) dst[m][k] = *(const PG8_LAS bf16x8*)(lds + PG8_SA(b, h) + aoff + m * 2048 + k * 1024); } } } while (0)
#define PG8_LDB(dst, b, h) do { _Pragma("unroll") for (int n = 0; n < 2; ++n) { if constexpr (FP8) dst##8[n] = cat8(*(const PG8_LAS bf16x8*)(lds + PG8_SB(b, h) + boff + n * 2048), *(const PG8_LAS bf16x8*)(lds + PG8_SB(b, h) + boff + n * 2048 + 1024)); \
        else { _Pragma("unroll") for (int k = 0; k < 2; ++k) dst[n][k] = *(const PG8_LAS bf16x8*)(lds + PG8_SB(b, h) + boff + n * 2048 + k * 1024); } } } while (0)
#define PG8_MMA(ai, bj, At, Bt) do { __builtin_amdgcn_s_setprio(1); _Pragma("unroll") for (int m = 0; m < 4; ++m) _Pragma("unroll") for (int n = 0; n < 2; ++n) { \
        if constexpr (FP8) asm volatile("v_mfma_scale_f32_16x16x128_f8f6f4 %0, %1, %2, %0, %3, %3 op_sel_hi:[0,0,0]" : "+v"(acc[ai][bj][m][n]) : "v"(Bt##8[n]), "v"(At##8[m]), "v"(fp8_unit_scale)); \
        else { _Pragma("unroll") for (int k = 0; k < 2; ++k) acc[ai][bj][m][n] = __builtin_amdgcn_mfma_f32_16x16x32_bf16(Bt[n][k], At[m][k], acc[ai][bj][m][n], 0, 0, 0); } } __builtin_amdgcn_s_setprio(0); } while (0)
#define PG8_WAIT_V(n) asm volatile("s_waitcnt vmcnt(" #n ")" ::: "memory")
#define PG8_WAIT_L(n) asm volatile("s_waitcnt lgkmcnt(" #n ")" ::: "memory")
#define PG8_BAR __builtin_amdgcn_s_barrier()
#define PG8_SCHED __builtin_amdgcn_sched_barrier(0)
    Unit cur, nxt; int ui = 0;
    if (!S.next(0, cur)) return;
    f32x4 acc[2][2][4][2];
#pragma unroll
    for (int a = 0; a < 2; ++a)
#pragma unroll
        for (int b = 0; b < 2; ++b)
#pragma unroll
            for (int m = 0; m < 4; ++m)
#pragma unroll
                for (int n = 0; n < 2; ++n) acc[a][b][m][n] = (f32x4){0.f, 0.f, 0.f, 0.f};
    int fp8_unit_scale = 0x7F7F7F7F; asm volatile("" : "+v"(fp8_unit_scale));
    bf16x8 At[4][2], B0[2][2], B1[2][2];
    i32x8 At8[4], B08[2], B18[2];
    const char* cA = (const char*)g.A + (size_t)cur.pm * tstepA; const char* cB = (const char*)g.Bt + (size_t)cur.pn * tstepB;
    S.a_ready(cur);
    if constexpr (SP2) {
        PG8_STAGE(PG8_SB(0, 0), cB, voffB); PG8_STAGE(PG8_SB(0, 1), cB + hstepB, voffB); PG8_STAGE(PG8_SA(0, 0), cA, voffA); PG8_STAGE(PG8_SA(0, 1), cA + hstepA, voffA);
        if (wr == 1) PG8_BAR;
        PG8_WAIT_V(2); PG8_BAR;
        PG8_STAGE(PG8_SB(1, 0), cB + kstep, voffB); PG8_STAGE(PG8_SA(1, 0), cA + kstep, voffA); PG8_STAGE(PG8_SB(1, 1), cB + hstepB + kstep, voffB);
        PG8_WAIT_V(6); PG8_BAR;
    } else {
        PG8_STAGE(PG8_SB(0, 0), cB, voffB); PG8_STAGE(PG8_SA(0, 0), cA, voffA); PG8_STAGE(PG8_SB(0, 1), cB + hstepB, voffB); PG8_STAGE(PG8_SA(0, 1), cA + hstepA, voffA);
        if (wr == 1) PG8_BAR;
        PG8_WAIT_V(4); PG8_BAR;
        PG8_STAGE(PG8_SB(1, 0), cB + kstep, voffB); PG8_STAGE(PG8_SA(1, 0), cA + kstep, voffA); PG8_STAGE(PG8_SB(1, 1), cB + hstepB + kstep, voffB);
        PG8_WAIT_V(6); PG8_BAR;
    }
    for (;;) {
        const bool has_next = S.next(ui + 1, nxt);
        const char* nA = has_next ? (const char*)g.A + (size_t)nxt.pm * tstepA : cA; const char* nB = has_next ? (const char*)g.Bt + (size_t)nxt.pn * tstepB : cB;
        for (int t = 0; t < nt; t += 2) {
            const bool last = (t == nt - 2);
            const char* a1 = cA + (size_t)(t + 1) * kstep;
            const char* a2 = last ? nA : cA + (size_t)(t + 2) * kstep; const char* b2 = last ? nB : cB + (size_t)(t + 2) * kstep;
            const char* a3 = a2 + kstep; const char* b3 = b2 + kstep;
            if (last && has_next) S.a_ready(nxt);
            if constexpr (SP2) {
            PG8_LDB(B0, 0, 0); PG8_LDB(B1, 0, 1); PG8_SCHED; PG8_LDA(At, 0, 0); PG8_STAGE(PG8_SA(1, 1), a1 + hstepA, voffA);
            PG8_WAIT_V(8); PG8_WAIT_L(0); PG8_BAR; PG8_MMA(0, 0, At, B0); PG8_MMA(0, 1, At, B1); PG8_BAR; PG8_SCHED;
            PG8_LDA(At, 0, 1); PG8_STAGE(PG8_SB(0, 0), b2, voffB); PG8_STAGE(PG8_SB(0, 1), b2 + hstepB, voffB); PG8_STAGE(PG8_SA(0, 0), a2, voffA);
            PG8_WAIT_V(8); PG8_WAIT_L(0); PG8_BAR; PG8_MMA(1, 0, At, B0); PG8_MMA(1, 1, At, B1); PG8_BAR; PG8_SCHED;
            PG8_LDB(B0, 1, 0); PG8_LDB(B1, 1, 1); PG8_SCHED; PG8_LDA(At, 1, 0); PG8_STAGE(PG8_SA(0, 1), a2 + hstepA, voffA);
            PG8_WAIT_V(8); PG8_WAIT_L(0); PG8_BAR; PG8_MMA(0, 0, At, B0); PG8_MMA(0, 1, At, B1); PG8_BAR; PG8_SCHED;
            PG8_LDA(At, 1, 1); PG8_STAGE(PG8_SB(1, 0), b3, voffB); PG8_STAGE(PG8_SB(1, 1), b3 + hstepB, voffB); PG8_STAGE(PG8_SA(1, 0), a3, voffA);
            PG8_WAIT_V(8); PG8_WAIT_L(0); PG8_BAR; PG8_MMA(1, 0, At, B0); PG8_MMA(1, 1, At, B1); PG8_BAR; PG8_SCHED;
            } else {
            PG8_LDB(B0, 0, 0); PG8_SCHED; PG8_LDA(At, 0, 0); PG8_STAGE(PG8_SA(1, 1), a1 + hstepA, voffA);
            PG8_WAIT_L(8); PG8_BAR; PG8_WAIT_L(0); PG8_MMA(0, 0, At, B0); PG8_BAR; PG8_SCHED;
            PG8_LDB(B1, 0, 1); PG8_STAGE(PG8_SB(0, 0), b2, voffB);
            PG8_BAR; PG8_WAIT_L(0); PG8_MMA(0, 1, At, B1); PG8_BAR;
            PG8_LDA(At, 0, 1); PG8_STAGE(PG8_SA(0, 0), a2, voffA);
            PG8_BAR; PG8_WAIT_L(0); PG8_MMA(1, 0, At, B0); PG8_BAR; PG8_SCHED;
            PG8_STAGE(PG8_SB(0, 1), b2 + hstepB, voffB);
            PG8_WAIT_V(6); PG8_BAR; PG8_MMA(1, 1, At, B1); PG8_BAR;
            PG8_LDB(B0, 1, 0); PG8_SCHED; PG8_LDA(At, 1, 0); PG8_STAGE(PG8_SA(0, 1), a2 + hstepA, voffA);
            PG8_WAIT_L(8); PG8_BAR; PG8_WAIT_L(0); PG8_MMA(0, 0, At, B0); PG8_BAR; PG8_SCHED;
            PG8_LDB(B1, 1, 1); PG8_STAGE(PG8_SB(1, 0), b3, voffB);
            PG8_BAR; PG8_WAIT_L(0); PG8_MMA(0, 1, At, B1); PG8_BAR;
            PG8_LDA(At, 1, 1); PG8_STAGE(PG8_SA(1, 0), a3, voffA);
            PG8_BAR; PG8_WAIT_L(0); PG8_MMA(1, 0, At, B0); PG8_BAR; PG8_SCHED;
            PG8_STAGE(PG8_SB(1, 1), b3 + hstepB, voffB);
            PG8_WAIT_V(6); PG8_BAR; PG8_MMA(1, 1, At, B1); PG8_BAR;
            }
        }
        if constexpr (ALIGN_EPI) { if (wr == 0) PG8_BAR; }
        if constexpr (FP8) asm volatile("s_nop 7\n\ts_nop 7" ::: "memory");
        if constexpr (!Epi::AFTER_DRAIN) { E(acc, cur, wr, wc, fr, fq); S.done(cur); }
        if (!has_next) break;
#pragma unroll
        for (int a = 0; a < 2; ++a)
#pragma unroll
            for (int b = 0; b < 2; ++b)
#pragma unroll
                for (int m = 0; m < 4; ++m)
#pragma unroll
                    for (int n = 0; n < 2; ++n) acc[a][b][m][n] = (f32x4){0.f, 0.f, 0.f, 0.f};
        cur = nxt; cA = nA; cB = nB; ++ui;
        if constexpr (ALIGN_EPI) { if (wr == 1) PG8_BAR; }
    }
    PG8_WAIT_V(0);
    if constexpr (!ALIGN_EPI) { if (wr == 0) PG8_BAR; }
    PG8_BAR;
    if constexpr (Epi::AFTER_DRAIN) { E.fused(acc, cur, wr, wc, fr, fq, lds, wid, lane); S.done(cur); }
#undef PG8_SA
#undef PG8_SB
#undef PG8_STAGE
#undef PG8_LDA
#undef PG8_LDB
#undef PG8_MMA
#undef PG8_WAIT_V
#undef PG8_WAIT_L
#undef PG8_BAR
#undef PG8_SCHED
}
template <class Epi, class Sched, bool FP8 = false>
__device__ __forceinline__ void gemm_phase_gather(PG8_LAS unsigned char* lds, const Gemm g, const Sched& S, const Epi& E) {
    const int tid = threadIdx.x, wid = __builtin_amdgcn_readfirstlane(tid >> 6), lane = tid & 63, wr = wid >> 2, wc = wid & 3, fr = lane & 15, fq = lane >> 4;
    const int K = g.K, nt = K / BK;
    unsigned voffB[2]; int RA[2], CA[2];
#pragma unroll
    for (int i = 0; i < 2; ++i) { int R, C; stage_rc(tid * 16 + i * 8192, R, C); const int Rb = Epi::PERM ? ((R & ~31) + perm32(R & 31)) : R;
        RA[i] = R; CA[i] = C; voffB[i] = (unsigned)(Rb * g.ldb + C) * 2u; }
    const size_t kstep = (size_t)(BK * 2);
    const size_t hstepB = (size_t)HALF * g.ldb * 2, tstepB = 2 * hstepB;
    const unsigned ldsw = (unsigned)wid * 1024u;
    const int aoff = lds_byte(wr * 64 + fr, fq * 8), boff = lds_byte(wc * 32 + fr, fq * 8);
#define PG8_SA(b, h) (((b) * 2 + (h)) * HTB)
#define PG8_SB(b, h) ((4 + (b) * 2 + (h)) * HTB)
#define PG8_STAGE(bufoff, gbase, voff) do { _Pragma("unroll") for (int _i = 0; _i < 2; ++_i) \
        __builtin_amdgcn_global_load_lds((const unsigned*)((const char*)(gbase) + (voff)[_i]), (PG8_LAS unsigned*)(lds + (bufoff) + ldsw + _i * 8192), 16, 0, 0); } while (0)
#define PG8_LDA(dst, b, h) do { _Pragma("unroll") for (int m = 0; m < 4; ++m) { if constexpr (FP8) dst##8[m] = cat8(*(const PG8_LAS bf16x8*)(lds + PG8_SA(b, h) + aoff + m * 2048), *(const PG8_LAS bf16x8*)(lds + PG8_SA(b, h) + aoff + m * 2048 + 1024)); \
        else { _Pragma("unroll") for (int k = 0; k < 2; ++k) dst[m][k] = *(const PG8_LAS bf16x8*)(lds + PG8_SA(b, h) + aoff + m * 2048 + k * 1024); } } } while (0)
#define PG8_LDB(dst, b, h) do { _Pragma("unroll") for (int n = 0; n < 2; ++n) { if constexpr (FP8) dst##8[n] = cat8(*(const PG8_LAS bf16x8*)(lds + PG8_SB(b, h) + boff + n * 2048), *(const PG8_LAS bf16x8*)(lds + PG8_SB(b, h) + boff + n * 2048 + 1024)); \
        else { _Pragma("unroll") for (int k = 0; k < 2; ++k) dst[n][k] = *(const PG8_LAS bf16x8*)(lds + PG8_SB(b, h) + boff + n * 2048 + k * 1024); } } } while (0)
#define PG8_MMA(ai, bj, At, Bt) do { __builtin_amdgcn_s_setprio(1); _Pragma("unroll") for (int m = 0; m < 4; ++m) _Pragma("unroll") for (int n = 0; n < 2; ++n) { \
        if constexpr (FP8) asm volatile("v_mfma_scale_f32_16x16x128_f8f6f4 %0, %1, %2, %0, %3, %3 op_sel_hi:[0,0,0]" : "+v"(acc[ai][bj][m][n]) : "v"(Bt##8[n]), "v"(At##8[m]), "v"(fp8_unit_scale)); \
        else { _Pragma("unroll") for (int k = 0; k < 2; ++k) acc[ai][bj][m][n] = __builtin_amdgcn_mfma_f32_16x16x32_bf16(Bt[n][k], At[m][k], acc[ai][bj][m][n], 0, 0, 0); } } __builtin_amdgcn_s_setprio(0); } while (0)
#define PG8_WAIT_V(n) asm volatile("s_waitcnt vmcnt(" #n ")" ::: "memory")
#define PG8_WAIT_L(n) asm volatile("s_waitcnt lgkmcnt(" #n ")" ::: "memory")
#define PG8_BAR __builtin_amdgcn_s_barrier()
#define PG8_SCHED __builtin_amdgcn_sched_barrier(0)
#define PG8_ROWS(dst, ui_) do { _Pragma("unroll") for (int _h = 0; _h < 2; ++_h) _Pragma("unroll") for (int _i = 0; _i < 2; ++_i) \
        dst[_h][_i] = (unsigned)S.row_token((ui_), _h * HALF + RA[_i]) * (unsigned)(g.lda * 2) + (unsigned)(CA[_i] * 2); } while (0)
    Unit cur, nxt; int ui = 0;
    if (!S.next(0, cur)) return;
    f32x4 acc[2][2][4][2];
#pragma unroll
    for (int a = 0; a < 2; ++a)
#pragma unroll
        for (int b = 0; b < 2; ++b)
#pragma unroll
            for (int m = 0; m < 4; ++m)
#pragma unroll
                for (int n = 0; n < 2; ++n) acc[a][b][m][n] = (f32x4){0.f, 0.f, 0.f, 0.f};
    int fp8_unit_scale = 0x7F7F7F7F; asm volatile("" : "+v"(fp8_unit_scale));
    bf16x8 At[4][2], B0[2][2], B1[2][2];
    i32x8 At8[4], B08[2], B18[2];
    unsigned offC[2][2];
    PG8_ROWS(offC, 0);
    const char* gA = (const char*)g.A;
    const char* cB = (const char*)g.Bt + (size_t)cur.pn * tstepB;
    PG8_STAGE(PG8_SB(0, 0), cB, voffB); PG8_STAGE(PG8_SB(0, 1), cB + hstepB, voffB); PG8_STAGE(PG8_SA(0, 0), gA, offC[0]); PG8_STAGE(PG8_SA(0, 1), gA, offC[1]);
    if (wr == 1) PG8_BAR;
    PG8_WAIT_V(2); PG8_BAR;
    PG8_STAGE(PG8_SB(1, 0), cB + kstep, voffB); PG8_STAGE(PG8_SA(1, 0), gA + kstep, offC[0]); PG8_STAGE(PG8_SB(1, 1), cB + hstepB + kstep, voffB);
    PG8_WAIT_V(6); PG8_BAR;
    for (;;) {
        const bool has_next = S.next(ui + 1, nxt);
        const char* nB = has_next ? (const char*)g.Bt + (size_t)nxt.pn * tstepB : cB;
        for (int t = 0; t < nt; t += 2) {
            const bool last = (t == nt - 2);
            const char* a1 = gA + (size_t)(t + 1) * kstep;
            const char* a2 = last ? gA : gA + (size_t)(t + 2) * kstep; const char* b2 = last ? nB : cB + (size_t)(t + 2) * kstep;
            const char* a3 = a2 + kstep; const char* b3 = b2 + kstep;
            PG8_LDB(B0, 0, 0); PG8_LDB(B1, 0, 1); PG8_SCHED; PG8_LDA(At, 0, 0); PG8_STAGE(PG8_SA(1, 1), a1, offC[1]);
            if (last && has_next) { PG8_ROWS(offC, ui + 1); }
            PG8_WAIT_V(8); PG8_WAIT_L(0); PG8_BAR; PG8_MMA(0, 0, At, B0); PG8_MMA(0, 1, At, B1); PG8_BAR; PG8_SCHED;
            PG8_LDA(At, 0, 1); PG8_STAGE(PG8_SB(0, 0), b2, voffB); PG8_STAGE(PG8_SB(0, 1), b2 + hstepB, voffB); PG8_STAGE(PG8_SA(0, 0), a2, offC[0]);
            PG8_WAIT_V(8); PG8_WAIT_L(0); PG8_BAR; PG8_MMA(1, 0, At, B0); PG8_MMA(1, 1, At, B1); PG8_BAR; PG8_SCHED;
            PG8_LDB(B0, 1, 0); PG8_LDB(B1, 1, 1); PG8_SCHED; PG8_LDA(At, 1, 0); PG8_STAGE(PG8_SA(0, 1), a2, offC[1]);
            PG8_WAIT_V(8); PG8_WAIT_L(0); PG8_BAR; PG8_MMA(0, 0, At, B0); PG8_MMA(0, 1, At, B1); PG8_BAR; PG8_SCHED;
            PG8_LDA(At, 1, 1); PG8_STAGE(PG8_SB(1, 0), b3, voffB); PG8_STAGE(PG8_SB(1, 1), b3 + hstepB, voffB); PG8_STAGE(PG8_SA(1, 0), a3, offC[0]);
            PG8_WAIT_V(8); PG8_WAIT_L(0); PG8_BAR; PG8_MMA(1, 0, At, B0); PG8_MMA(1, 1, At, B1); PG8_BAR; PG8_SCHED;
        }
        if (wr == 0) PG8_BAR;
        if constexpr (FP8) asm volatile("s_nop 7\n\ts_nop 7" ::: "memory");
        E(acc, cur, wr, wc, fr, fq); S.done(cur);
        if (!has_next) break;
#pragma unroll
        for (int a = 0; a < 2; ++a)
#pragma unroll
            for (int b = 0; b < 2; ++b)
#pragma unroll
                for (int m = 0; m < 4; ++m)
#pragma unroll
                    for (int n = 0; n < 2; ++n) acc[a][b][m][n] = (f32x4){0.f, 0.f, 0.f, 0.f};
        cur = nxt; cB = nB; ++ui;
        if (wr == 1) PG8_BAR;
    }
    PG8_WAIT_V(0);
    PG8_BAR;
#undef PG8_ROWS
#undef PG8_SA
#undef PG8_SB
#undef PG8_STAGE
#undef PG8_LDA
#undef PG8_LDB
#undef PG8_MMA
#undef PG8_WAIT_V
#undef PG8_WAIT_L
#undef PG8_BAR
#undef PG8_SCHED
}
}

#ifndef MOE_UP_FP8
#define MOE_UP_FP8 1
#endif
#ifndef PROBE_NOATOM
#define PROBE_NOATOM 0
#endif
constexpr int T = 8192, D = 2048, NL = 2, BW = 512, ZC = 14336, INC = 14352;
constexpr int NE = 64, NEX = 65  , ED = 512;
constexpr int HK = NEX * ED;
constexpr float ALPHA = 1.41421356237f;
constexpr float LN_EPS = 1e-5f;
constexpr float UPSC = MOE_UP_FP8 ? (1.f / 64.f) : 1.f;
constexpr int ZC_SBQ = 0, ZC_SBK = 512, ZC_SBV = 1024, ZC_GMU = 1536, ZC_GMV = 2048, ZC_GDN = 2560, ZC_GDNG = 4096,
              ZC_MLQ = 4608, ZC_MLK = 4864, ZC_MLV = 5120, ZC_MLO = 5632, ZC_GATE = 6144;

#define GAS __attribute__((address_space(1)))
#define LAS __attribute__((address_space(3)))
typedef unsigned short bf16;
typedef unsigned v4u __attribute__((ext_vector_type(4)));
typedef unsigned v2u __attribute__((ext_vector_type(2)));
typedef float v4f __attribute__((ext_vector_type(4)));
typedef float v2f __attribute__((ext_vector_type(2)));
#define LDS_WAIT() asm volatile("s_waitcnt lgkmcnt(0)" ::: "memory")
#define LDS_BAR() do { asm volatile("s_waitcnt lgkmcnt(0)" ::: "memory"); __builtin_amdgcn_s_barrier(); asm volatile("" ::: "memory"); } while (0)

constexpr size_t MiB = 1u << 20;
constexpr size_t WS_CTL = 0, CTL_ZERO_BYTES = 1 * MiB;
constexpr size_t WS_WIN = 2 * MiB, WS_WBR = 58 * MiB, WS_WOUT = 66 * MiB, WS_WUP = 74 * MiB, WS_WDN = 334 * MiB;
constexpr size_t WS_XB = 464 * MiB, WS_SMALL = 496 * MiB, WS_EG = 497 * MiB, WS_BETA = WS_EG + 256 * 1024, WS_COMB = 498 * MiB;
constexpr size_t WS_Z = 500 * MiB, WS_GQ = 724 * MiB, WS_GK = 740 * MiB, WS_GV = 756 * MiB, WS_GO = 772 * MiB, WS_HO = 788 * MiB;
constexpr size_t WS_BR = 804 * MiB, WS_MTMP = 836 * MiB, WS_MSUM = 900 * MiB, WS_Y = 932 * MiB, WS_X1 = 996 * MiB, WS_X1B = 1060 * MiB;
constexpr size_t WS_XCUR = 1092 * MiB, WS_HB = 1156 * MiB, WS_YEXP = 1236 * MiB, WS_LIST = 1524 * MiB, WS_WL = 1526 * MiB, WS_SLOT = 1528 * MiB, WS_MQ = 1530 * MiB, WS_MS = 1534 * MiB, WS_MK = 1538 * MiB, WS_MV = 1542 * MiB, WS_MFL = 1552 * MiB, WS_HDEN = WS_MFL + 65536, WS_VT = 1553 * MiB, WS_END = 1561 * MiB;
constexpr size_t WS_GU = WS_GQ, WS_GNW = WS_GK, WS_GQG = WS_GK + 8 * MiB, WS_GKT = WS_GV, WS_GAT = WS_GV + 8 * MiB, WS_GDL = WS_GV + 12 * MiB;
constexpr int HROWS = 73728;
static_assert(WS_HB + (size_t)HROWS * ED * 2 <= WS_YEXP && WS_YEXP + (size_t)HROWS * D * 2 <= WS_LIST, "ws map (moe)");
static_assert(WS_WIN + (size_t)ZC * D * 2 <= WS_WBR && WS_WUP + (size_t)NEX * 1024 * D * 2 <= WS_WDN && WS_WDN + (size_t)D * HK * 2 <= WS_XB, "ws map (weights)");
static_assert(WS_Z + (size_t)T * ZC * 2 <= WS_GQ, "ws map (acts)");
constexpr int CW_BAR = 4096, CW_CNT = 16384;
constexpr int TAB_OFF = 131072 + 1024;
constexpr int LDS_BYTES = 163840, MISC_OFF = 131072 + 320;

__device__ __forceinline__ float bflo(unsigned w) { return __uint_as_float(w << 16); }
__device__ __forceinline__ float bfhi(unsigned w) { return __uint_as_float(w & 0xffff0000u); }
__device__ __forceinline__ unsigned f2bf(float f) { unsigned u = __float_as_uint(f); return (u + 0x7fffu + ((u >> 16) & 1u)) >> 16; }
__device__ __forceinline__ unsigned pk2(float lo, float hi) { return f2bf(lo) | (f2bf(hi) << 16); }
template <int CTRL> __device__ __forceinline__ float dpp(float x) { return __builtin_bit_cast(float, __builtin_amdgcn_mov_dpp(__builtin_bit_cast(int, x), CTRL, 0xf, 0xf, true)); }
__device__ __forceinline__ float sum4(float x) { x += dpp<0xB1>(x); x += dpp<0x4E>(x); return x; }
__device__ __forceinline__ float sum8(float x) { x = sum4(x); x += dpp<0x141>(x); return x; }
__device__ __forceinline__ float sum16(float x) { x = sum8(x); x += dpp<0x140>(x); return x; }
__device__ __forceinline__ float wave_sum(float x) { x = sum16(x); x += __shfl_xor(x, 16); x += __shfl_xor(x, 32); return x; }
__device__ __forceinline__ float max8(float x) { x = fmaxf(x, dpp<0xB1>(x)); x = fmaxf(x, dpp<0x4E>(x)); x = fmaxf(x, dpp<0x141>(x)); return x; }
__device__ __forceinline__ float min8(float x) { x = fminf(x, dpp<0xB1>(x)); x = fminf(x, dpp<0x4E>(x)); x = fminf(x, dpp<0x141>(x)); return x; }
__device__ __forceinline__ float wave_scan_incl(float v) {
    v += __builtin_bit_cast(float, __builtin_amdgcn_update_dpp(0, __builtin_bit_cast(int, v), 0x111, 0xf, 0xf, true));
    v += __builtin_bit_cast(float, __builtin_amdgcn_update_dpp(0, __builtin_bit_cast(int, v), 0x112, 0xf, 0xf, true));
    v += __builtin_bit_cast(float, __builtin_amdgcn_update_dpp(0, __builtin_bit_cast(int, v), 0x114, 0xf, 0xf, true));
    v += __builtin_bit_cast(float, __builtin_amdgcn_update_dpp(0, __builtin_bit_cast(int, v), 0x118, 0xf, 0xf, true));
    v += __builtin_bit_cast(float, __builtin_amdgcn_update_dpp(0, __builtin_bit_cast(int, v), 0x142, 0xa, 0xf, false));
    v += __builtin_bit_cast(float, __builtin_amdgcn_update_dpp(0, __builtin_bit_cast(int, v), 0x143, 0xc, 0xf, false));
    return v;
}
__device__ __forceinline__ float sigmoidf_(float x) { return 1.f / (1.f + __expf(-x)); }
__device__ __forceinline__ float siluf_(float x) { return x / (1.f + __expf(-x)); }
__device__ __forceinline__ float softplusf_(float x) { return fmaxf(x, 0.f) + __logf(1.f + __expf(-fabsf(x))); }
__device__ __forceinline__ float gelu_tanh(float x) { const float y = 0.7978845608f * (x + 0.044715f * x * x * x); const float t = 1.f - 2.f / (__expf(2.f * y) + 1.f); return 0.5f * x * (1.f + t); }
__device__ __forceinline__ void unpack8(const v4u r, float (&f)[8]) { f[0] = bflo(r.x); f[1] = bfhi(r.x); f[2] = bflo(r.y); f[3] = bfhi(r.y); f[4] = bflo(r.z); f[5] = bfhi(r.z); f[6] = bflo(r.w); f[7] = bfhi(r.w); }
#define XB_TMO      128
#define XB_XCNT(j)  (256  + 64 * (j))
#define XB_XSUB(j)  (1280 + 64 * (j))
#define XB_XGEN(j)  (2304 + 64 * (j))
#define XB_TOP      3328
#define XB_TOPGEN   3392
#define XCD_BAR_WORDS 3456
#define XB_SPIN_CAP (1u << 18)

__device__ __forceinline__ unsigned xb_ld(unsigned* p)              { return __hip_atomic_load(p, __ATOMIC_RELAXED, __HIP_MEMORY_SCOPE_AGENT); }
__device__ __forceinline__ unsigned xb_add(unsigned* p, unsigned v) { return __hip_atomic_fetch_add(p, v, __ATOMIC_RELAXED, __HIP_MEMORY_SCOPE_AGENT); }
__device__ __forceinline__ unsigned xb_xcc_id() { return (unsigned)__builtin_amdgcn_s_getreg((3 << 11) | 20) & 0xFu; }
#define XB_SPIN(cond, bar) do { unsigned _sp = 0; while (cond) { __builtin_amdgcn_s_sleep(1); \
    if ((++_sp & 255u) == 0u) { if (xb_ld(&(bar)[XB_TMO])) break; if (_sp > XB_SPIN_CAP) { atomicAdd(&(bar)[XB_TMO], 1u); break; } } } } while (0)

struct XcdBarrier {
    unsigned* bar; unsigned x;
    volatile LAS unsigned* st;
};

__device__ __forceinline__ XcdBarrier xcd_barrier_post(unsigned* bar, volatile LAS unsigned* st) {
    XcdBarrier b; b.bar = bar; b.x = xb_xcc_id(); b.st = st;
    if (threadIdx.x == 0) (void)xb_add(&bar[XB_XCNT(b.x)], 1u);
    return b;
}
__device__ __forceinline__ void xcd_barrier_complete(unsigned* bar, unsigned x, unsigned& nloc, unsigned& nx) {
    const unsigned G = gridDim.x * gridDim.y * gridDim.z;
    unsigned sum, cnt, mine, sp = 0u;
    for (;;) {
        sum = 0u; cnt = 0u; mine = 0u;
#pragma unroll
        for (unsigned j = 0; j < 16; ++j) { const unsigned c = xb_ld(&bar[XB_XCNT(j)]); sum += c; cnt += (c > 0u) ? 1u : 0u; mine = (j == x) ? c : mine; }
        if (sum == G) break;
        __builtin_amdgcn_s_sleep(1);
        if ((++sp & 255u) == 0u) { if (xb_ld(&bar[XB_TMO])) break; if (sp > XB_SPIN_CAP) { atomicAdd(&bar[XB_TMO], 1u); break; } }
    }
    nloc = mine > 0u ? mine : 1u; nx = cnt > 0u ? cnt : 1u;
}

__device__ __forceinline__ void xcd_barrier(const XcdBarrier& b) {
    asm volatile("s_waitcnt vmcnt(0)" ::: "memory");
    __syncthreads();
    if (threadIdx.x == 0) {
        unsigned* bar = b.bar;
        __builtin_amdgcn_s_waitcnt(0);
        unsigned nloc = b.st[0], nx = b.st[1];
        if (nloc == 0u) { xcd_barrier_complete(bar, b.x, nloc, nx); b.st[0] = nloc; b.st[1] = nx; }
        const unsigned old = xb_add(&bar[XB_XSUB(b.x)], 1u);
        const unsigned gen = old / nloc;
        if (old + 1u == (gen + 1u) * nloc) {
            __builtin_amdgcn_fence(__ATOMIC_RELEASE, "agent");
            asm volatile("s_waitcnt vmcnt(0)" ::: "memory");
            const unsigned og = xb_add(&bar[XB_TOP], 1u);
            const unsigned tg = og / nx;
            if (og + 1u == (tg + 1u) * nx) xb_add(&bar[XB_TOPGEN], 1u);
            else XB_SPIN(xb_ld(&bar[XB_TOPGEN]) == tg, bar);
            __builtin_amdgcn_fence(__ATOMIC_ACQUIRE, "agent");
            xb_add(&bar[XB_XGEN(b.x)], 1u);
            asm volatile("s_waitcnt vmcnt(0)" ::: "memory");
        } else {
            XB_SPIN(xb_ld(&bar[XB_XGEN(b.x)]) == gen, bar);
            __builtin_amdgcn_fence(__ATOMIC_ACQUIRE, "agent");
            asm volatile("s_waitcnt vmcnt(0)" ::: "memory");
        }
    }
    __syncthreads();
}

struct Params { const float* in[27]; float* out; unsigned char* ws; int ph_lo, ph_hi; };
enum { I_X = 0, I_WIN, I_GMNG, I_GMNB, I_GMWS, I_GMBS, I_CONVW, I_ALOG, I_DTB, I_GDNNG, I_MLIB, I_MLFB, I_MLNG, I_WBR, I_WOUT, I_LN1G, I_LN1B,
       I_WR, I_RB, I_WG, I_WU, I_WD, I_SG, I_SU, I_SD, I_LN2G, I_LN2B };

using pg8::f32x4; using pg8::u32x4; using pg8::Unit; using pg8::HALF; using pg8::BM;

struct MergeOrder {
    int G, c;
    __device__ bool next(int i, Unit& u) const {
        const long L = (long)(i >> 2) * G + c; if (L >= 256) return false;
        const int g = i & 3; int wgid = (int)L; { const int q = 256 / 8, xcd = wgid % 8, off = wgid / 8; wgid = xcd * q + off; }
        const int nN = 8, nig = 8 * nN, gid = wgid / nig, fm = gid * 8; const int pm = fm + ((wgid % nig) % 8), pn = (wgid % nig) / 8;
        u.pm = g * 32 + pm; u.pn = g * 8 + pn; return true;
    }
    __device__ __forceinline__ void a_ready(const Unit&) const {}
    __device__ __forceinline__ void done(const Unit&) const {}
};
struct EpiMerge {
    static constexpr bool PERM = true, AFTER_DRAIN = false;
    const bf16* Z; float* tmp; bf16* msum;
    __device__ __forceinline__ void operator()(const f32x4 (&acc)[2][2][4][2], const Unit& u, int wr, int wc, int fr, int fq) const {
        const int g = u.pm >> 5, pm = u.pm & 31, pn = u.pn & 7;
        const int row0 = pm * BM + wr * 64 + fr, col0 = pn * BM + wc * 32 + 8 * fq;
#pragma unroll
        for (int ai = 0; ai < 2; ++ai)
#pragma unroll
            for (int m = 0; m < 4; ++m) { const size_t row = (size_t)(row0 + ai * HALF + m * 16);
#pragma unroll
                for (int bj = 0; bj < 2; ++bj) { const int col = col0 + bj * HALF;
                    const v4u gr = *(const v4u*)(Z + row * ZC + ZC_GATE + g * D + col); float gl[8]; unpack8(gr, gl);
                    float* tp = tmp + row * D + col; f32x4 v0 = acc[ai][bj][m][0], v1 = acc[ai][bj][m][1];
#pragma unroll
                    for (int j = 0; j < 4; ++j) { v0[j] *= sigmoidf_(gl[j]); v1[j] *= sigmoidf_(gl[4 + j]); }
                    if (g > 0) { v0 += *(const f32x4*)tp; v1 += *(const f32x4*)(tp + 4); }
                    if (g < 3) { *(f32x4*)tp = v0; *(f32x4*)(tp + 4) = v1; }
                    else { unsigned w0 = 0, w1 = 0; w0 = __builtin_amdgcn_cvt_pk_fp8_f32(v0[0], v0[1], w0, false); w0 = __builtin_amdgcn_cvt_pk_fp8_f32(v0[2], v0[3], w0, true); w1 = __builtin_amdgcn_cvt_pk_fp8_f32(v1[0], v1[1], w1, false); w1 = __builtin_amdgcn_cvt_pk_fp8_f32(v1[2], v1[3], w1, true);
                        *(v2u*)((unsigned char*)msum + row * D + col) = (v2u){w0, w1}; } }
                asm volatile("" ::: "memory"); }
    }
};
struct EpiResid {
    static constexpr bool PERM = false, AFTER_DRAIN = false;
    const float* X; float* Y; float sc;
    __device__ __forceinline__ void operator()(const f32x4 (&acc)[2][2][4][2], const Unit& u, int wr, int wc, int fr, int fq) const {
        const int row0 = u.pm * BM + wr * 64 + fr, col0 = u.pn * BM + wc * 32 + 4 * fq;
#pragma unroll
        for (int ai = 0; ai < 2; ++ai)
#pragma unroll
            for (int m = 0; m < 4; ++m) { const size_t off = (size_t)(row0 + ai * HALF + m * 16) * D + col0;
#pragma unroll
                for (int bj = 0; bj < 2; ++bj)
#pragma unroll
                    for (int n = 0; n < 2; ++n) { const f32x4 xv = *(const f32x4*)(X + off + bj * HALF + n * 16); *(f32x4*)(Y + off + bj * HALF + n * 16) = xv * ALPHA + acc[ai][bj][m][n] * sc; } }
    }
};
struct MoeTab {
    LAS int* t; LAS unsigned short* tok; LAS float* wt; LAS unsigned char* mte;
    __device__ __forceinline__ MoeTab(LAS unsigned char* lds) : t((LAS int*)(lds + TAB_OFF)), tok((LAS unsigned short*)(lds + TAB_OFF + 1024)), wt((LAS float*)(lds + TAB_OFF + 5120)), mte((LAS unsigned char*)(lds + TAB_OFF + 13312)) {}
};
__device__ __forceinline__ void moe_tables(const MoeTab& M, const unsigned* cnt  , int tid, int lane, int wave) {
    __syncthreads();
    if (wave == 0) { const int c = (int)cnt[64 * lane]; const int tiles = (c + 255) >> 8; const float incl = wave_scan_incl((float)tiles);
        M.t[80 + lane] = c; M.t[lane] = (int)incl - tiles; if (lane == 63) { M.t[64] = (int)incl; M.t[65] = (int)incl + T / 256; M.t[80 + 64] = T; } }
    __syncthreads();
    const int Mt = M.t[65];
    for (int mt = tid; mt < Mt; mt += 512) { int e = 0;
        for (int k = 1; k <= 64; ++k) e = (M.t[k] <= mt) ? k : e;
        M.mte[mt] = (unsigned char)e; }
    __syncthreads();
}
struct UpOrder {
    MoeTab M; int n;
    __device__ __forceinline__ bool next(int i, Unit& u) const { if (i >= n) return false; u.pm = M.t[168 + i]; u.pn = M.t[176 + i]; u.aux = i; return true; }
    __device__ __forceinline__ int row_token(int i, int r) const { return (int)M.tok[i * 256 + r]; }
    __device__ __forceinline__ void a_ready(const Unit&) const {}
    __device__ __forceinline__ void done(const Unit&) const {}
};
__device__ __forceinline__ int up_order_build(const MoeTab& M, const int* LIST, const float* WL, int wg, int G, int tid) {
    const int U = 4 * M.t[65];
    if (tid < 8) { const int L = tid * G + wg; if (L < U) { const int mt = L >> 2, q = L & 3, e = M.mte[mt]; M.t[168 + tid] = mt; M.t[176 + tid] = e * 4 + q; M.t[184 + tid] = e; M.t[192 + tid] = mt - M.t[e]; } }
    int n = 0;
#pragma unroll
    for (int i = 0; i < 8; ++i) n += (i * G + wg < U) ? 1 : 0;
    __syncthreads();
    for (int idx = tid; idx < n * 256; idx += 512) { const int i = idx >> 8, r = idx & 255, e = M.t[184 + i], li = M.t[192 + i] * 256 + r;
        int tk = 0; float w = 0.f;
        if (e < NE) { if (li < M.t[80 + e]) { tk = LIST[e * T + li]; w = WL[e * T + li]; } } else { tk = li; w = 1.f; }
        M.tok[idx] = (unsigned short)tk; M.wt[idx] = w; }
    __syncthreads();
    return n;
}
struct EpiGluSparse {
    static constexpr bool PERM = true, AFTER_DRAIN = false;
    LAS const float* wt; bf16* H;
    __device__ __forceinline__ void operator()(const f32x4 (&acc)[2][2][4][2], const Unit& u, int wr, int wc, int fr, int fq) const {
        const int q = u.pn & 3; const int rl0 = wr * 64 + fr, col0 = q * 128 + wc * 32 + 8 * fq;
#pragma unroll
        for (int ai = 0; ai < 2; ++ai)
#pragma unroll
            for (int m = 0; m < 4; ++m) { const int rl = rl0 + ai * HALF + m * 16; const float c = wt[u.aux * 256 + rl]; float h[8];
#pragma unroll
                for (int n = 0; n < 2; ++n)
#pragma unroll
                    for (int j = 0; j < 4; ++j) h[4 * n + j] = siluf_(acc[ai][0][m][n][j] * UPSC) * (acc[ai][1][m][n][j] * UPSC) * c;
                u32x4 w; w.x = pk2(h[0], h[1]); w.y = pk2(h[2], h[3]); w.z = pk2(h[4], h[5]); w.w = pk2(h[6], h[7]);
                *(u32x4*)(H + ((size_t)u.pm * 256 + rl) * ED + col0) = w; }
    }
};
struct DownOrder {
    MoeTab M; int G, c, U;
    __device__ __forceinline__ bool next(int i, Unit& u) const { const int L = i * G + c; if (L >= U) return false; const int mt = L >> 3; u.pm = mt; u.pn = (int)M.mte[mt] * 8 + (L & 7); u.aux = 0; return true; }
    __device__ __forceinline__ void a_ready(const Unit&) const {}
    __device__ __forceinline__ void done(const Unit&) const {}
};
struct EpiYexp {
    static constexpr bool PERM = true, AFTER_DRAIN = false;
    bf16* Y;
    __device__ __forceinline__ void operator()(const f32x4 (&acc)[2][2][4][2], const Unit& u, int wr, int wc, int fr, int fq) const {
        const int row0 = u.pm * BM + wr * 64 + fr, col0 = (u.pn & 7) * BM + wc * 32 + 8 * fq;
#pragma unroll
        for (int ai = 0; ai < 2; ++ai)
#pragma unroll
            for (int m = 0; m < 4; ++m) { bf16* rowp = Y + (size_t)(row0 + ai * HALF + m * 16) * D + col0;
#pragma unroll
                for (int bj = 0; bj < 2; ++bj) { const f32x4 v0 = acc[ai][bj][m][0], v1 = acc[ai][bj][m][1];
                    u32x4 w; w.x = pk2(v0[0], v0[1]); w.y = pk2(v0[2], v0[3]); w.z = pk2(v1[0], v1[1]); w.w = pk2(v1[2], v1[3]); *(u32x4*)(rowp + bj * HALF) = w; } }
    }
};

struct TrItem { const float* src; bf16* dst; unsigned sld, dld; int f8; };
__device__ __forceinline__ void tr_load(const TrItem& t, int lane, v4f (&v)[8]) { const int r8 = lane >> 3, c4 = lane & 7;
#pragma unroll
    for (int i = 0; i < 8; ++i) v[i] = *(const v4f*)(t.src + (size_t)(8 * i + r8) * t.sld + 4 * c4); }
__device__ __forceinline__ void tr_store(const TrItem& t, const v4f (&v)[8], LAS float* scr, int lane) {
    { const int r8 = lane >> 3, c4 = lane & 7;
#pragma unroll
      for (int i = 0; i < 8; ++i) { LAS float* d = scr + (8 * i + r8) * 33 + 4 * c4; d[0] = v[i].x; d[1] = v[i].y; d[2] = v[i].z; d[3] = v[i].w; } }
    LDS_WAIT(); asm volatile("" ::: "memory");
    if (t.f8) {
        const int c = lane & 3;
#pragma unroll
        for (int j = 0; j < 2; ++j) { const int n = (lane >> 2) + 16 * j; const LAS float* s = scr + (16 * c) * 33 + n; unsigned w[4];
#pragma unroll
            for (int q = 0; q < 4; ++q) { unsigned x = 0; x = __builtin_amdgcn_cvt_pk_fp8_f32(s[(4 * q) * 33] * 64.f, s[(4 * q + 1) * 33] * 64.f, x, false); x = __builtin_amdgcn_cvt_pk_fp8_f32(s[(4 * q + 2) * 33] * 64.f, s[(4 * q + 3) * 33] * 64.f, x, true); w[q] = x; }
            *(v4u*)((unsigned char*)t.dst + (size_t)n * t.dld + 16 * c) = (v4u){w[0], w[1], w[2], w[3]}; }
    } else {
        const int c = lane & 7;
#pragma unroll
        for (int j = 0; j < 4; ++j) { const int n = (lane >> 3) + 8 * j; const LAS float* s = scr + (8 * c) * 33 + n;
            v4u o; o.x = pk2(s[0 * 33], s[1 * 33]); o.y = pk2(s[2 * 33], s[3 * 33]); o.z = pk2(s[4 * 33], s[5 * 33]); o.w = pk2(s[6 * 33], s[7 * 33]);
            *(v4u*)(t.dst + (size_t)n * t.dld + 8 * c) = o; }
    }
    LDS_WAIT(); asm volatile("" ::: "memory");
}
template <int PART> __device__ __forceinline__ TrItem tr_decode(const Params& p, int l, int it) {
    unsigned char* ws = p.ws;
    constexpr int N_IN = (ZC / 32) * (D / 64), N_BR = 4 * (BW / 64) * (D / 32), N_OUT = (D / 64) * (D / 32), N_UP = NEX * 2 * (D / 64) * (ED / 32);
    int r = it; TrItem t; t.f8 = 0;
    if (PART == 0) {
        const float* w_in = p.in[I_WIN] + (size_t)l * D * INC; const float* w_br = p.in[I_WBR] + (size_t)l * 4 * BW * D; const float* w_out = p.in[I_WOUT] + (size_t)l * D * D;
        bf16* WIN = (bf16*)(ws + WS_WIN); bf16* WBR = (bf16*)(ws + WS_WBR); bf16* WOUT = (bf16*)(ws + WS_WOUT);
        if (r < N_IN) { const int kb = r / (ZC / 32), n0 = (r % (ZC / 32)) * 32, k0 = kb * 64; const int sc = n0 + (n0 >= ZC_GATE ? 16 : (n0 >= ZC_MLQ ? 8 : 0));
            t.src = w_in + (size_t)k0 * INC + sc; t.sld = INC; t.dst = (bf16*)((unsigned char*)WIN + (size_t)n0 * D + k0); t.dld = D; t.f8 = 1; return t; } r -= N_IN;
        if (r < N_BR) { const int g = r / 512, rr = r % 512, k0 = (rr / 64) * 64, n0 = (rr % 64) * 32;
            t.src = w_br + ((size_t)g * BW + k0) * D + n0; t.sld = D; t.dst = WBR + ((size_t)g * D + n0) * BW + k0; t.dld = BW; return t; } r -= N_BR;
        { const int k0 = (r / 64) * 64, n0 = (r % 64) * 32; t.src = w_out + (size_t)k0 * D + n0; t.sld = D; t.dst = (bf16*)((unsigned char*)WOUT + (size_t)n0 * D + k0); t.dld = D; t.f8 = 1; return t; }
    } else {
        const float* w_g = p.in[I_WG] + (size_t)l * NE * D * ED; const float* w_u = p.in[I_WU] + (size_t)l * NE * D * ED; const float* w_d = p.in[I_WD] + (size_t)l * NE * ED * D;
        const float* s_g = p.in[I_SG] + (size_t)l * D * ED; const float* s_u = p.in[I_SU] + (size_t)l * D * ED; const float* s_d = p.in[I_SD] + (size_t)l * ED * D;
        bf16* WUP = (bf16*)(ws + WS_WUP); bf16* WDN = (bf16*)(ws + WS_WDN);
        if (r < N_UP) { const int e = r / 1024, rr = r % 1024, mat = rr / 512, r2 = rr % 512, k0 = (r2 / 16) * 64, n0 = (r2 % 16) * 32;
            const float* sb = (e < NE) ? ((mat ? w_u : w_g) + (size_t)e * D * ED) : (mat ? s_u : s_g);
            const int drow = e * 1024 + (n0 / 128) * 256 + mat * 128 + (n0 % 128);
            t.src = sb + (size_t)k0 * ED + n0; t.sld = ED;
#if MOE_UP_FP8
            t.dst = (bf16*)((unsigned char*)WUP + (size_t)drow * D + k0); t.dld = D; t.f8 = 1; return t; }
#else
            t.dst = WUP + (size_t)drow * D + k0; t.dld = D; return t; }
#endif
        r -= N_UP;
        { const int e = r / 512, rr = r % 512, k0 = (rr / 64) * 64, n0 = (rr % 64) * 32;
            const float* sb = (e < NE) ? (w_d + (size_t)e * ED * D) : s_d;
            t.src = sb + (size_t)k0 * D + n0; t.sld = D; t.dst = WDN + ((size_t)e * D + n0) * ED + k0; t.dld = ED; return t; }
    }
}
template <int PART> __device__ __forceinline__ void phase_convert(const Params& p, int l, LAS unsigned char* lds, int gw, int NGW, int wave, int lane) {
    constexpr int N_IN = (ZC / 32) * (D / 64), N_BR = 4 * (BW / 64) * (D / 32), N_OUT = (D / 64) * (D / 32), N_UP = NEX * 2 * (D / 64) * (ED / 32), N_DN = NEX * (ED / 64) * (D / 32);
    constexpr int NITEMS = (PART == 0) ? (N_IN + N_BR + N_OUT) : (N_UP + N_DN);
    LAS float* scr = (LAS float*)(lds + wave * 16384);
    if (gw >= NITEMS) return;
    TrItem cur = tr_decode<PART>(p, l, gw); v4f va[8], vb[8];
    tr_load(cur, lane, va);
    for (int it = gw; it < NITEMS; it += 2 * NGW) {
        const int i1 = it + NGW, i2 = it + 2 * NGW; TrItem nx = cur;
        if (i1 < NITEMS) { nx = tr_decode<PART>(p, l, i1); } tr_load(nx, lane, vb);
        tr_store(cur, va, scr, lane);
        if (i1 >= NITEMS) break;
        cur = nx; if (i2 < NITEMS) { cur = tr_decode<PART>(p, l, i2); } tr_load(cur, lane, va);
        tr_store(nx, vb, scr, lane);
        if (i2 >= NITEMS) break;
    }
}
__device__ __forceinline__ void phase_xprep(const Params& p, int l, const float* xin, LAS unsigned char* lds, int gw, int NGW, int tid, int lane) {
    const float* w_in = p.in[I_WIN] + (size_t)l * D * INC; LAS float* wsm = (LAS float*)lds;
    __syncthreads();
    for (int idx = tid; idx < D * 16; idx += 512) { const int d = idx >> 4, c = idx & 15; wsm[c * D + d] = w_in[(size_t)d * INC + (c < 8 ? 4608 + c : 6152 + (c - 8))]; }
    __syncthreads();
    bf16* XB = (bf16*)(p.ws + WS_XB); float* SMALL = (float*)(p.ws + WS_SMALL);
    for (int m = gw; m < T; m += NGW) {
        const v4f* xr = (const v4f*)(xin + (size_t)m * D) + lane; v4f v[8];
#pragma unroll
        for (int j = 0; j < 8; ++j) v[j] = xr[64 * j];
        unsigned* xo = (unsigned*)((unsigned char*)XB + (size_t)m * D) + lane;
#pragma unroll
        for (int j = 0; j < 8; ++j) { unsigned w = 0; w = __builtin_amdgcn_cvt_pk_fp8_f32(v[j].x, v[j].y, w, false); w = __builtin_amdgcn_cvt_pk_fp8_f32(v[j].z, v[j].w, w, true); xo[64 * j] = w; }
        float res = 0.f;
#pragma unroll 1
        for (int c = 0; c < 16; ++c) { float a = 0.f;
#pragma unroll
            for (int j = 0; j < 8; ++j) { const v4f w = *(const LAS v4f*)(wsm + c * D + 4 * lane + 256 * j); a += v[j].x * w.x + v[j].y * w.y + v[j].z * w.z + v[j].w * w.w; }
            a = wave_sum(a); if (lane == c) res = a; }
        if (lane < 16) SMALL[(size_t)m * 16 + lane] = res;
    }
    __syncthreads();
}


typedef short bf16x8_t __attribute__((ext_vector_type(8)));
__device__ __forceinline__ void ml_pre_item(const Params& p, int l, LAS unsigned char* lds, int item, int tid, int wave, int lane) {
    const int h = item & 3, n = item >> 2; const size_t t0 = (size_t)n * 64;
    const bf16* Z = (const bf16*)(p.ws + WS_Z); const float* SMALL = (const float*)(p.ws + WS_SMALL);
    bf16* MQ = (bf16*)(p.ws + WS_MQ) + (size_t)item * 4096; bf16* MS = (bf16*)(p.ws + WS_MS) + (size_t)item * 4096; bf16* MK = (bf16*)(p.ws + WS_MK) + (size_t)item * 4096;
    bf16* MV = (bf16*)(p.ws + WS_MV) + (size_t)item * 9216; float* MFL = (float*)(p.ws + WS_MFL);
    LAS float* qs = (LAS float*)lds;
    LAS float* ks = qs + 64 * 65;
    LAS float* bs = ks + 64 * 65;
    LAS unsigned short* vs = (LAS unsigned short*)(bs + 128);
    { const int tk = tid >> 3, c8 = tid & 7; float f[8];
      unpack8(*(const v4u*)(Z + (t0 + tk) * ZC + ZC_MLQ + h * 64 + 8 * c8), f);
#pragma unroll
      for (int i = 0; i < 8; ++i) qs[tk * 65 + 8 * c8 + i] = f[i];
      unpack8(*(const v4u*)(Z + (t0 + tk) * ZC + ZC_MLK + h * 64 + 8 * c8), f);
#pragma unroll
      for (int i = 0; i < 8; ++i) ks[tk * 65 + 8 * c8 + i] = f[i]; }
#pragma unroll
    for (int r = 0; r < 2; ++r) { const int idx = tid + 512 * r, tk = idx >> 4, c8 = idx & 15;
        *(LAS v4u*)(vs + tk * 136 + 8 * c8) = *(const v4u*)(Z + (t0 + tk) * ZC + ZC_MLV + h * 128 + 8 * c8); }
    if (wave == 0) { const float fp = SMALL[(t0 + lane) * 16 + 12 + h] + p.in[I_MLFB][l * 4 + h]; const float lf = -softplusf_(-fp);
        bs[lane] = wave_scan_incl(lf); bs[64 + lane] = SMALL[(t0 + lane) * 16 + 8 + h] + p.in[I_MLIB][l * 4 + h]; }
    __syncthreads();
    const float blast = bs[63];
    { const int i = tid >> 3, jb = tid & 7; const float bi = bs[i];
      { const float e = __expf(bi) * 0.125f; float o[8];
#pragma unroll
        for (int x = 0; x < 8; ++x) o[x] = qs[i * 65 + 8 * jb + x] * e;
        v4u w; w.x = pk2(o[0], o[1]); w.y = pk2(o[2], o[3]); w.z = pk2(o[4], o[5]); w.w = pk2(o[6], o[7]); *(v4u*)(MQ + i * 64 + 8 * jb) = w; }
      { float d[8];
#pragma unroll
        for (int x = 0; x < 8; ++x) d[x] = 0.f;
        if (8 * jb <= i) {
            for (int dd = 0; dd < 64; ++dd) { const float qv = qs[i * 65 + dd];
#pragma unroll
                for (int x = 0; x < 8; ++x) d[x] += qv * ks[(8 * jb + x) * 65 + dd]; }
#pragma unroll
            for (int x = 0; x < 8; ++x) { const int j = 8 * jb + x; d[x] = (j <= i) ? __expf(bi - bs[j] + bs[64 + j]) * d[x] * 0.125f : 0.f; } }
        v4u w; w.x = pk2(d[0], d[1]); w.y = pk2(d[2], d[3]); w.z = pk2(d[4], d[5]); w.w = pk2(d[6], d[7]); *(v4u*)(MS + i * 64 + 8 * jb) = w; }
      { float o[8];
#pragma unroll
        for (int x = 0; x < 8; ++x) { const int j = 8 * jb + x; o[x] = ks[j * 65 + i] * __expf(blast - bs[j] + bs[64 + j]); }
        v4u w; w.x = pk2(o[0], o[1]); w.y = pk2(o[2], o[3]); w.z = pk2(o[4], o[5]); w.w = pk2(o[6], o[7]); *(v4u*)(MK + i * 64 + 8 * jb) = w; }
    }
    { const int c = tid >> 2, jq = tid & 3; unsigned w[8];
#pragma unroll
      for (int x = 0; x < 8; ++x) w[x] = (unsigned)vs[(16 * jq + 2 * x) * 136 + c] | ((unsigned)vs[(16 * jq + 2 * x + 1) * 136 + c] << 16);
      *(v4u*)(MV + c * 64 + 16 * jq) = (v4u){w[0], w[1], w[2], w[3]}; *(v4u*)(MV + c * 64 + 16 * jq + 8) = (v4u){w[4], w[5], w[6], w[7]};
      if (tid < 64) { const int c2 = 128 + (tid >> 2); const unsigned one = (c2 == 128) ? 0x3F803F80u : 0u;
          *(v4u*)(MV + c2 * 64 + 16 * jq) = (v4u){one, one, one, one}; *(v4u*)(MV + c2 * 64 + 16 * jq + 8) = (v4u){one, one, one, one}; } }
    if (tid == 0) MFL[item] = __expf(blast);
    __syncthreads();
}
struct MlFrags { bf16x8_t q[2], s[2], kt[2], vt[2]; float fl; };
__device__ __forceinline__ void ml_load(MlFrags& F, const Params& p, int item, int offA, int offV) {
    const bf16* MQ = (const bf16*)(p.ws + WS_MQ) + (size_t)item * 4096; const bf16* MS = (const bf16*)(p.ws + WS_MS) + (size_t)item * 4096; const bf16* MK = (const bf16*)(p.ws + WS_MK) + (size_t)item * 4096;
    const bf16* MV = (const bf16*)(p.ws + WS_MV) + (size_t)item * 9216;
#pragma unroll
    for (int ks = 0; ks < 2; ++ks) { F.q[ks] = *(const bf16x8_t*)(MQ + offA + 32 * ks); F.s[ks] = *(const bf16x8_t*)(MS + offA + 32 * ks); F.kt[ks] = *(const bf16x8_t*)(MK + offA + 32 * ks); F.vt[ks] = *(const bf16x8_t*)(MV + offV + 32 * ks); }
    F.fl = ((const float*)(p.ws + WS_MFL))[item];
}
__device__ __forceinline__ void ml_seq(const Params& p, LAS unsigned char* lds, int wgi, int wave, int lane) {
    const int u = wgi * 2 + (wave >> 2), wi = wave & 3, h = u / 9, sl = u % 9, g = lane >> 4, c = lane & 15;
    LAS unsigned short* CT = (LAS unsigned short*)(lds + (wave >> 2) * 4096);
    float* HO = (float*)(p.ws + WS_HO); float* HDEN = (float*)(p.ws + WS_HDEN);
    const int offA = (16 * wi + c) * 64 + 8 * g, offV = (16 * sl + c) * 64 + 8 * g;
    *(LAS v2u*)(CT + c * 64 + 16 * wi + 4 * g) = (v2u){0u, 0u};
    pg8::f32x4 Cacc = {0.f, 0.f, 0.f, 0.f};
    __syncthreads();
    MlFrags F0, F1;
    ml_load(F0, p, h, offA, offV);
#define ML_STEP(F, n_) do { const int cur = (n_) & 1; \
        const bf16x8_t c0 = *(const LAS bf16x8_t*)(CT + cur * 1024 + c * 64 + 8 * g), c1 = *(const LAS bf16x8_t*)(CT + cur * 1024 + c * 64 + 32 + 8 * g); \
        pg8::f32x4 num = {0.f, 0.f, 0.f, 0.f}; \
        num = __builtin_amdgcn_mfma_f32_16x16x32_bf16(F.q[0], c0, num, 0, 0, 0); num = __builtin_amdgcn_mfma_f32_16x16x32_bf16(F.q[1], c1, num, 0, 0, 0); \
        num = __builtin_amdgcn_mfma_f32_16x16x32_bf16(F.s[0], F.vt[0], num, 0, 0, 0); num = __builtin_amdgcn_mfma_f32_16x16x32_bf16(F.s[1], F.vt[1], num, 0, 0, 0); \
        Cacc = Cacc * F.fl; \
        Cacc = __builtin_amdgcn_mfma_f32_16x16x32_bf16(F.kt[0], F.vt[0], Cacc, 0, 0, 0); Cacc = __builtin_amdgcn_mfma_f32_16x16x32_bf16(F.kt[1], F.vt[1], Cacc, 0, 0, 0); \
        { v2u w; w.x = pk2(Cacc[0], Cacc[1]); w.y = pk2(Cacc[2], Cacc[3]); *(LAS v2u*)(CT + (cur ^ 1) * 1024 + c * 64 + 16 * wi + 4 * g) = w; } \
        { const size_t tb = (size_t)(n_) * 64 + 16 * wi + 4 * g; \
          if (sl < 8) { _Pragma("unroll") for (int r = 0; r < 4; ++r) HO[(tb + r) * BW + h * 128 + 16 * sl + c] = num[r]; } \
          else if (c == 0) { _Pragma("unroll") for (int r = 0; r < 4; ++r) HDEN[(tb + r) * 4 + h] = num[r]; } } \
        LDS_BAR(); } while (0)
    for (int n = 0; n < T / 64; n += 2) {
        ml_load(F1, p, (n + 1) * 4 + h, offA, offV);
        ML_STEP(F0, n);
        ml_load(F0, p, ((n + 2 < T / 64) ? n + 2 : n) * 4 + h, offA, offV);
        ML_STEP(F1, n + 1);
    }
#undef ML_STEP
}


constexpr int QP = 132;
__device__ __forceinline__ void gdn_pre_item(const Params& p, int l, LAS unsigned char* lds, int item, int tid, int wave, int lane) {
    const int h = item & 3, n = item >> 2; const size_t t0 = (size_t)n * 64;
    const bf16* Z = (const bf16*)(p.ws + WS_Z); const float* SMALL = (const float*)(p.ws + WS_SMALL);
    float* GU = (float*)(p.ws + WS_GU) + (size_t)item * 8192; bf16* GNW = (bf16*)(p.ws + WS_GNW) + (size_t)item * 8192; bf16* GQG = (bf16*)(p.ws + WS_GQG) + (size_t)item * 8192;
    bf16* GAT = (bf16*)(p.ws + WS_GAT) + (size_t)item * 4096; bf16* GKT = (bf16*)(p.ws + WS_GKT) + (size_t)item * 8192; float* GDL = (float*)(p.ws + WS_GDL);
    const float* cw = p.in[I_CONVW] + (size_t)l * 4 * 1536;
    LAS float* qs = (LAS float*)lds; LAS float* ks = qs + 64 * QP; LAS float* vs = ks + 64 * QP; LAS float* Ls = vs + 64 * QP;   LAS float* gcs = Ls + 64 * 68; LAS float* bts = gcs + 64; LAS float* btg = bts + 64;
    { const int tk = tid >> 3, part = tid & 7;
#pragma unroll 1
      for (int i = 0; i < 3; ++i) { float a[16];
#pragma unroll
        for (int x = 0; x < 16; ++x) a[x] = 0.f;
#pragma unroll
        for (int j = 0; j < 4; ++j) { const long tt = (long)t0 + tk - 3 + j; if (tt >= 0) {
            const bf16* src = Z + (size_t)tt * ZC + ZC_GDN + i * 512 + h * 128 + 16 * part; float x0[8], x1[8]; unpack8(*(const v4u*)src, x0); unpack8(*(const v4u*)(src + 8), x1);
            const float* wp = cw + j * 1536 + i * 512 + h * 128 + 16 * part;
#pragma unroll
            for (int x = 0; x < 8; ++x) { a[x] += wp[x] * x0[x]; a[8 + x] += wp[8 + x] * x1[x]; } } }
        float ss = 0.f;
#pragma unroll
        for (int x = 0; x < 16; ++x) { a[x] = siluf_(a[x]); ss += a[x] * a[x]; }
        if (i < 2) { ss = sum8(ss); const float r = rsqrtf(ss + 1e-6f) * (i == 0 ? 0.08838834764831845f : 1.f);
#pragma unroll
            for (int x = 0; x < 16; ++x) a[x] *= r; }
        LAS float* dst = (i == 0 ? qs : (i == 1 ? ks : vs)) + tk * QP + 16 * part;
#pragma unroll
        for (int x4 = 0; x4 < 4; ++x4) *(LAS v4f*)(dst + 4 * x4) = (v4f){a[4 * x4], a[4 * x4 + 1], a[4 * x4 + 2], a[4 * x4 + 3]}; } }
    if (wave == 0) { const float bb = SMALL[(t0 + lane) * 16 + h], aa = SMALL[(t0 + lane) * 16 + 4 + h];
        const float g = -__expf(p.in[I_ALOG][l * 4 + h]) * softplusf_(aa + p.in[I_DTB][l * 4 + h]);
        const float gc = wave_scan_incl(g), bt = sigmoidf_(bb); gcs[lane] = gc; bts[lane] = bt; btg[lane] = bt * __expf(gc); }
    __syncthreads();
    { const int i = tid >> 3, jb = tid & 7; const float gi = gcs[i], bi = bts[i]; float dk[8], dq[8];
#pragma unroll
      for (int x = 0; x < 8; ++x) { dk[x] = 0.f; dq[x] = 0.f; }
      if (8 * jb <= i) {
#pragma unroll 2
          for (int d4 = 0; d4 < 32; ++d4) { const v4f qi = *(const LAS v4f*)(qs + i * QP + 4 * d4), ki = *(const LAS v4f*)(ks + i * QP + 4 * d4);
#pragma unroll
              for (int x = 0; x < 8; ++x) { const v4f kj = *(const LAS v4f*)(ks + (8 * jb + x) * QP + 4 * d4);
                  dk[x] += ki.x * kj.x + ki.y * kj.y + ki.z * kj.z + ki.w * kj.w; dq[x] += qi.x * kj.x + qi.y * kj.y + qi.z * kj.z + qi.w * kj.w; } }
#pragma unroll
          for (int x = 0; x < 8; ++x) { const int j = 8 * jb + x; const float dc = __expf(gi - gcs[j]); dk[x] = (j < i) ? bi * dk[x] * dc : 0.f; dq[x] = (j <= i) ? dq[x] * dc : 0.f; } }
      *(LAS v4f*)(Ls + i * 68 + 8 * jb) = (v4f){dk[0], dk[1], dk[2], dk[3]}; *(LAS v4f*)(Ls + i * 68 + 8 * jb + 4) = (v4f){dk[4], dk[5], dk[6], dk[7]};
      v4u w; w.x = pk2(dq[0], dq[1]); w.y = pk2(dq[2], dq[3]); w.z = pk2(dq[4], dq[5]); w.w = pk2(dq[6], dq[7]); *(v4u*)(GAT + i * 64 + 8 * jb) = w; }
    __syncthreads();
    if (tid < 256) {
        const int c = tid; int vz; asm volatile("v_mov_b32 %0, 0" : "=v"(vz));
        const LAS float* rp = (c < 128) ? (vs + c) : (ks + (c - 128)); const LAS float* mp = ((c < 128) ? bts : btg) + vz;
#define GDN_RHS(i) (rp[(i) * QP] * mp[(i)])
#define GDN_L4(i, j4) (*(const LAS v4f*)(Ls + (i) * 68 + 4 * (j4) + vz))
        float x0 = GDN_RHS(0); __builtin_amdgcn_sched_barrier(0);
        float x1 = GDN_RHS(1); { const v4f l = GDN_L4(1, 0); x1 -= l.x * x0; } __builtin_amdgcn_sched_barrier(0);
        float x2 = GDN_RHS(2); { const v4f l = GDN_L4(2, 0); x2 -= l.x * x0; x2 -= l.y * x1; } __builtin_amdgcn_sched_barrier(0);
        float x3 = GDN_RHS(3); { const v4f l = GDN_L4(3, 0); x3 -= l.x * x0; x3 -= l.y * x1; x3 -= l.z * x2; } __builtin_amdgcn_sched_barrier(0);
        float x4 = GDN_RHS(4); { const v4f l = GDN_L4(4, 0); x4 -= l.x * x0; x4 -= l.y * x1; x4 -= l.z * x2; x4 -= l.w * x3; } __builtin_amdgcn_sched_barrier(0);
        float x5 = GDN_RHS(5); { const v4f l = GDN_L4(5, 0); x5 -= l.x * x0; x5 -= l.y * x1; x5 -= l.z * x2; x5 -= l.w * x3; } { const v4f l = GDN_L4(5, 1); x5 -= l.x * x4; } __builtin_amdgcn_sched_barrier(0);
        float x6 = GDN_RHS(6); { const v4f l = GDN_L4(6, 0); x6 -= l.x * x0; x6 -= l.y * x1; x6 -= l.z * x2; x6 -= l.w * x3; } { const v4f l = GDN_L4(6, 1); x6 -= l.x * x4; x6 -= l.y * x5; } __builtin_amdgcn_sched_barrier(0);
        float x7 = GDN_RHS(7); { const v4f l = GDN_L4(7, 0); x7 -= l.x * x0; x7 -= l.y * x1; x7 -= l.z * x2; x7 -= l.w * x3; } { const v4f l = GDN_L4(7, 1); x7 -= l.x * x4; x7 -= l.y * x5; x7 -= l.z * x6; } __builtin_amdgcn_sched_barrier(0);
        float x8 = GDN_RHS(8); { const v4f l = GDN_L4(8, 0); x8 -= l.x * x0; x8 -= l.y * x1; x8 -= l.z * x2; x8 -= l.w * x3; } { const v4f l = GDN_L4(8, 1); x8 -= l.x * x4; x8 -= l.y * x5; x8 -= l.z * x6; x8 -= l.w * x7; } __builtin_amdgcn_sched_barrier(0);
        float x9 = GDN_RHS(9); { const v4f l = GDN_L4(9, 0); x9 -= l.x * x0; x9 -= l.y * x1; x9 -= l.z * x2; x9 -= l.w * x3; } { const v4f l = GDN_L4(9, 1); x9 -= l.x * x4; x9 -= l.y * x5; x9 -= l.z * x6; x9 -= l.w * x7; } { const v4f l = GDN_L4(9, 2); x9 -= l.x * x8; } __builtin_amdgcn_sched_barrier(0);
        float x10 = GDN_RHS(10); { const v4f l = GDN_L4(10, 0); x10 -= l.x * x0; x10 -= l.y * x1; x10 -= l.z * x2; x10 -= l.w * x3; } { const v4f l = GDN_L4(10, 1); x10 -= l.x * x4; x10 -= l.y * x5; x10 -= l.z * x6; x10 -= l.w * x7; } { const v4f l = GDN_L4(10, 2); x10 -= l.x * x8; x10 -= l.y * x9; } __builtin_amdgcn_sched_barrier(0);
        float x11 = GDN_RHS(11); { const v4f l = GDN_L4(11, 0); x11 -= l.x * x0; x11 -= l.y * x1; x11 -= l.z * x2; x11 -= l.w * x3; } { const v4f l = GDN_L4(11, 1); x11 -= l.x * x4; x11 -= l.y * x5; x11 -= l.z * x6; x11 -= l.w * x7; } { const v4f l = GDN_L4(11, 2); x11 -= l.x * x8; x11 -= l.y * x9; x11 -= l.z * x10; } __builtin_amdgcn_sched_barrier(0);
        float x12 = GDN_RHS(12); { const v4f l = GDN_L4(12, 0); x12 -= l.x * x0; x12 -= l.y * x1; x12 -= l.z * x2; x12 -= l.w * x3; } { const v4f l = GDN_L4(12, 1); x12 -= l.x * x4; x12 -= l.y * x5; x12 -= l.z * x6; x12 -= l.w * x7; } { const v4f l = GDN_L4(12, 2); x12 -= l.x * x8; x12 -= l.y * x9; x12 -= l.z * x10; x12 -= l.w * x11; } __builtin_amdgcn_sched_barrier(0);
        float x13 = GDN_RHS(13); { const v4f l = GDN_L4(13, 0); x13 -= l.x * x0; x13 -= l.y * x1; x13 -= l.z * x2; x13 -= l.w * x3; } { const v4f l = GDN_L4(13, 1); x13 -= l.x * x4; x13 -= l.y * x5; x13 -= l.z * x6; x13 -= l.w * x7; } { const v4f l = GDN_L4(13, 2); x13 -= l.x * x8; x13 -= l.y * x9; x13 -= l.z * x10; x13 -= l.w * x11; } { const v4f l = GDN_L4(13, 3); x13 -= l.x * x12; } __builtin_amdgcn_sched_barrier(0);
        float x14 = GDN_RHS(14); { const v4f l = GDN_L4(14, 0); x14 -= l.x * x0; x14 -= l.y * x1; x14 -= l.z * x2; x14 -= l.w * x3; } { const v4f l = GDN_L4(14, 1); x14 -= l.x * x4; x14 -= l.y * x5; x14 -= l.z * x6; x14 -= l.w * x7; } { const v4f l = GDN_L4(14, 2); x14 -= l.x * x8; x14 -= l.y * x9; x14 -= l.z * x10; x14 -= l.w * x11; } { const v4f l = GDN_L4(14, 3); x14 -= l.x * x12; x14 -= l.y * x13; } __builtin_amdgcn_sched_barrier(0);
        float x15 = GDN_RHS(15); { const v4f l = GDN_L4(15, 0); x15 -= l.x * x0; x15 -= l.y * x1; x15 -= l.z * x2; x15 -= l.w * x3; } { const v4f l = GDN_L4(15, 1); x15 -= l.x * x4; x15 -= l.y * x5; x15 -= l.z * x6; x15 -= l.w * x7; } { const v4f l = GDN_L4(15, 2); x15 -= l.x * x8; x15 -= l.y * x9; x15 -= l.z * x10; x15 -= l.w * x11; } { const v4f l = GDN_L4(15, 3); x15 -= l.x * x12; x15 -= l.y * x13; x15 -= l.z * x14; } __builtin_amdgcn_sched_barrier(0);
        float x16 = GDN_RHS(16); { const v4f l = GDN_L4(16, 0); x16 -= l.x * x0; x16 -= l.y * x1; x16 -= l.z * x2; x16 -= l.w * x3; } { const v4f l = GDN_L4(16, 1); x16 -= l.x * x4; x16 -= l.y * x5; x16 -= l.z * x6; x16 -= l.w * x7; } { const v4f l = GDN_L4(16, 2); x16 -= l.x * x8; x16 -= l.y * x9; x16 -= l.z * x10; x16 -= l.w * x11; } { const v4f l = GDN_L4(16, 3); x16 -= l.x * x12; x16 -= l.y * x13; x16 -= l.z * x14; x16 -= l.w * x15; } __builtin_amdgcn_sched_barrier(0);
        float x17 = GDN_RHS(17); { const v4f l = GDN_L4(17, 0); x17 -= l.x * x0; x17 -= l.y * x1; x17 -= l.z * x2; x17 -= l.w * x3; } { const v4f l = GDN_L4(17, 1); x17 -= l.x * x4; x17 -= l.y * x5; x17 -= l.z * x6; x17 -= l.w * x7; } { const v4f l = GDN_L4(17, 2); x17 -= l.x * x8; x17 -= l.y * x9; x17 -= l.z * x10; x17 -= l.w * x11; } { const v4f l = GDN_L4(17, 3); x17 -= l.x * x12; x17 -= l.y * x13; x17 -= l.z * x14; x17 -= l.w * x15; } { const v4f l = GDN_L4(17, 4); x17 -= l.x * x16; } __builtin_amdgcn_sched_barrier(0);
        float x18 = GDN_RHS(18); { const v4f l = GDN_L4(18, 0); x18 -= l.x * x0; x18 -= l.y * x1; x18 -= l.z * x2; x18 -= l.w * x3; } { const v4f l = GDN_L4(18, 1); x18 -= l.x * x4; x18 -= l.y * x5; x18 -= l.z * x6; x18 -= l.w * x7; } { const v4f l = GDN_L4(18, 2); x18 -= l.x * x8; x18 -= l.y * x9; x18 -= l.z * x10; x18 -= l.w * x11; } { const v4f l = GDN_L4(18, 3); x18 -= l.x * x12; x18 -= l.y * x13; x18 -= l.z * x14; x18 -= l.w * x15; } { const v4f l = GDN_L4(18, 4); x18 -= l.x * x16; x18 -= l.y * x17; } __builtin_amdgcn_sched_barrier(0);
        float x19 = GDN_RHS(19); { const v4f l = GDN_L4(19, 0); x19 -= l.x * x0; x19 -= l.y * x1; x19 -= l.z * x2; x19 -= l.w * x3; } { const v4f l = GDN_L4(19, 1); x19 -= l.x * x4; x19 -= l.y * x5; x19 -= l.z * x6; x19 -= l.w * x7; } { const v4f l = GDN_L4(19, 2); x19 -= l.x * x8; x19 -= l.y * x9; x19 -= l.z * x10; x19 -= l.w * x11; } { const v4f l = GDN_L4(19, 3); x19 -= l.x * x12; x19 -= l.y * x13; x19 -= l.z * x14; x19 -= l.w * x15; } { const v4f l = GDN_L4(19, 4); x19 -= l.x * x16; x19 -= l.y * x17; x19 -= l.z * x18; } __builtin_amdgcn_sched_barrier(0);
        float x20 = GDN_RHS(20); { const v4f l = GDN_L4(20, 0); x20 -= l.x * x0; x20 -= l.y * x1; x20 -= l.z * x2; x20 -= l.w * x3; } { const v4f l = GDN_L4(20, 1); x20 -= l.x * x4; x20 -= l.y * x5; x20 -= l.z * x6; x20 -= l.w * x7; } { const v4f l = GDN_L4(20, 2); x20 -= l.x * x8; x20 -= l.y * x9; x20 -= l.z * x10; x20 -= l.w * x11; } { const v4f l = GDN_L4(20, 3); x20 -= l.x * x12; x20 -= l.y * x13; x20 -= l.z * x14; x20 -= l.w * x15; } { const v4f l = GDN_L4(20, 4); x20 -= l.x * x16; x20 -= l.y * x17; x20 -= l.z * x18; x20 -= l.w * x19; } __builtin_amdgcn_sched_barrier(0);
        float x21 = GDN_RHS(21); { const v4f l = GDN_L4(21, 0); x21 -= l.x * x0; x21 -= l.y * x1; x21 -= l.z * x2; x21 -= l.w * x3; } { const v4f l = GDN_L4(21, 1); x21 -= l.x * x4; x21 -= l.y * x5; x21 -= l.z * x6; x21 -= l.w * x7; } { const v4f l = GDN_L4(21, 2); x21 -= l.x * x8; x21 -= l.y * x9; x21 -= l.z * x10; x21 -= l.w * x11; } { const v4f l = GDN_L4(21, 3); x21 -= l.x * x12; x21 -= l.y * x13; x21 -= l.z * x14; x21 -= l.w * x15; } { const v4f l = GDN_L4(21, 4); x21 -= l.x * x16; x21 -= l.y * x17; x21 -= l.z * x18; x21 -= l.w * x19; } { const v4f l = GDN_L4(21, 5); x21 -= l.x * x20; } __builtin_amdgcn_sched_barrier(0);
        float x22 = GDN_RHS(22); { const v4f l = GDN_L4(22, 0); x22 -= l.x * x0; x22 -= l.y * x1; x22 -= l.z * x2; x22 -= l.w * x3; } { const v4f l = GDN_L4(22, 1); x22 -= l.x * x4; x22 -= l.y * x5; x22 -= l.z * x6; x22 -= l.w * x7; } { const v4f l = GDN_L4(22, 2); x22 -= l.x * x8; x22 -= l.y * x9; x22 -= l.z * x10; x22 -= l.w * x11; } { const v4f l = GDN_L4(22, 3); x22 -= l.x * x12; x22 -= l.y * x13; x22 -= l.z * x14; x22 -= l.w * x15; } { const v4f l = GDN_L4(22, 4); x22 -= l.x * x16; x22 -= l.y * x17; x22 -= l.z * x18; x22 -= l.w * x19; } { const v4f l = GDN_L4(22, 5); x22 -= l.x * x20; x22 -= l.y * x21; } __builtin_amdgcn_sched_barrier(0);
        float x23 = GDN_RHS(23); { const v4f l = GDN_L4(23, 0); x23 -= l.x * x0; x23 -= l.y * x1; x23 -= l.z * x2; x23 -= l.w * x3; } { const v4f l = GDN_L4(23, 1); x23 -= l.x * x4; x23 -= l.y * x5; x23 -= l.z * x6; x23 -= l.w * x7; } { const v4f l = GDN_L4(23, 2); x23 -= l.x * x8; x23 -= l.y * x9; x23 -= l.z * x10; x23 -= l.w * x11; } { const v4f l = GDN_L4(23, 3); x23 -= l.x * x12; x23 -= l.y * x13; x23 -= l.z * x14; x23 -= l.w * x15; } { const v4f l = GDN_L4(23, 4); x23 -= l.x * x16; x23 -= l.y * x17; x23 -= l.z * x18; x23 -= l.w * x19; } { const v4f l = GDN_L4(23, 5); x23 -= l.x * x20; x23 -= l.y * x21; x23 -= l.z * x22; } __builtin_amdgcn_sched_barrier(0);
        float x24 = GDN_RHS(24); { const v4f l = GDN_L4(24, 0); x24 -= l.x * x0; x24 -= l.y * x1; x24 -= l.z * x2; x24 -= l.w * x3; } { const v4f l = GDN_L4(24, 1); x24 -= l.x * x4; x24 -= l.y * x5; x24 -= l.z * x6; x24 -= l.w * x7; } { const v4f l = GDN_L4(24, 2); x24 -= l.x * x8; x24 -= l.y * x9; x24 -= l.z * x10; x24 -= l.w * x11; } { const v4f l = GDN_L4(24, 3); x24 -= l.x * x12; x24 -= l.y * x13; x24 -= l.z * x14; x24 -= l.w * x15; } { const v4f l = GDN_L4(24, 4); x24 -= l.x * x16; x24 -= l.y * x17; x24 -= l.z * x18; x24 -= l.w * x19; } { const v4f l = GDN_L4(24, 5); x24 -= l.x * x20; x24 -= l.y * x21; x24 -= l.z * x22; x24 -= l.w * x23; } __builtin_amdgcn_sched_barrier(0);
        float x25 = GDN_RHS(25); { const v4f l = GDN_L4(25, 0); x25 -= l.x * x0; x25 -= l.y * x1; x25 -= l.z * x2; x25 -= l.w * x3; } { const v4f l = GDN_L4(25, 1); x25 -= l.x * x4; x25 -= l.y * x5; x25 -= l.z * x6; x25 -= l.w * x7; } { const v4f l = GDN_L4(25, 2); x25 -= l.x * x8; x25 -= l.y * x9; x25 -= l.z * x10; x25 -= l.w * x11; } { const v4f l = GDN_L4(25, 3); x25 -= l.x * x12; x25 -= l.y * x13; x25 -= l.z * x14; x25 -= l.w * x15; } { const v4f l = GDN_L4(25, 4); x25 -= l.x * x16; x25 -= l.y * x17; x25 -= l.z * x18; x25 -= l.w * x19; } { const v4f l = GDN_L4(25, 5); x25 -= l.x * x20; x25 -= l.y * x21; x25 -= l.z * x22; x25 -= l.w * x23; } { const v4f l = GDN_L4(25, 6); x25 -= l.x * x24; } __builtin_amdgcn_sched_barrier(0);
        float x26 = GDN_RHS(26); { const v4f l = GDN_L4(26, 0); x26 -= l.x * x0; x26 -= l.y * x1; x26 -= l.z * x2; x26 -= l.w * x3; } { const v4f l = GDN_L4(26, 1); x26 -= l.x * x4; x26 -= l.y * x5; x26 -= l.z * x6; x26 -= l.w * x7; } { const v4f l = GDN_L4(26, 2); x26 -= l.x * x8; x26 -= l.y * x9; x26 -= l.z * x10; x26 -= l.w * x11; } { const v4f l = GDN_L4(26, 3); x26 -= l.x * x12; x26 -= l.y * x13; x26 -= l.z * x14; x26 -= l.w * x15; } { const v4f l = GDN_L4(26, 4); x26 -= l.x * x16; x26 -= l.y * x17; x26 -= l.z * x18; x26 -= l.w * x19; } { const v4f l = GDN_L4(26, 5); x26 -= l.x * x20; x26 -= l.y * x21; x26 -= l.z * x22; x26 -= l.w * x23; } { const v4f l = GDN_L4(26, 6); x26 -= l.x * x24; x26 -= l.y * x25; } __builtin_amdgcn_sched_barrier(0);
        float x27 = GDN_RHS(27); { const v4f l = GDN_L4(27, 0); x27 -= l.x * x0; x27 -= l.y * x1; x27 -= l.z * x2; x27 -= l.w * x3; } { const v4f l = GDN_L4(27, 1); x27 -= l.x * x4; x27 -= l.y * x5; x27 -= l.z * x6; x27 -= l.w * x7; } { const v4f l = GDN_L4(27, 2); x27 -= l.x * x8; x27 -= l.y * x9; x27 -= l.z * x10; x27 -= l.w * x11; } { const v4f l = GDN_L4(27, 3); x27 -= l.x * x12; x27 -= l.y * x13; x27 -= l.z * x14; x27 -= l.w * x15; } { const v4f l = GDN_L4(27, 4); x27 -= l.x * x16; x27 -= l.y * x17; x27 -= l.z * x18; x27 -= l.w * x19; } { const v4f l = GDN_L4(27, 5); x27 -= l.x * x20; x27 -= l.y * x21; x27 -= l.z * x22; x27 -= l.w * x23; } { const v4f l = GDN_L4(27, 6); x27 -= l.x * x24; x27 -= l.y * x25; x27 -= l.z * x26; } __builtin_amdgcn_sched_barrier(0);
        float x28 = GDN_RHS(28); { const v4f l = GDN_L4(28, 0); x28 -= l.x * x0; x28 -= l.y * x1; x28 -= l.z * x2; x28 -= l.w * x3; } { const v4f l = GDN_L4(28, 1); x28 -= l.x * x4; x28 -= l.y * x5; x28 -= l.z * x6; x28 -= l.w * x7; } { const v4f l = GDN_L4(28, 2); x28 -= l.x * x8; x28 -= l.y * x9; x28 -= l.z * x10; x28 -= l.w * x11; } { const v4f l = GDN_L4(28, 3); x28 -= l.x * x12; x28 -= l.y * x13; x28 -= l.z * x14; x28 -= l.w * x15; } { const v4f l = GDN_L4(28, 4); x28 -= l.x * x16; x28 -= l.y * x17; x28 -= l.z * x18; x28 -= l.w * x19; } { const v4f l = GDN_L4(28, 5); x28 -= l.x * x20; x28 -= l.y * x21; x28 -= l.z * x22; x28 -= l.w * x23; } { const v4f l = GDN_L4(28, 6); x28 -= l.x * x24; x28 -= l.y * x25; x28 -= l.z * x26; x28 -= l.w * x27; } __builtin_amdgcn_sched_barrier(0);
        float x29 = GDN_RHS(29); { const v4f l = GDN_L4(29, 0); x29 -= l.x * x0; x29 -= l.y * x1; x29 -= l.z * x2; x29 -= l.w * x3; } { const v4f l = GDN_L4(29, 1); x29 -= l.x * x4; x29 -= l.y * x5; x29 -= l.z * x6; x29 -= l.w * x7; } { const v4f l = GDN_L4(29, 2); x29 -= l.x * x8; x29 -= l.y * x9; x29 -= l.z * x10; x29 -= l.w * x11; } { const v4f l = GDN_L4(29, 3); x29 -= l.x * x12; x29 -= l.y * x13; x29 -= l.z * x14; x29 -= l.w * x15; } { const v4f l = GDN_L4(29, 4); x29 -= l.x * x16; x29 -= l.y * x17; x29 -= l.z * x18; x29 -= l.w * x19; } { const v4f l = GDN_L4(29, 5); x29 -= l.x * x20; x29 -= l.y * x21; x29 -= l.z * x22; x29 -= l.w * x23; } { const v4f l = GDN_L4(29, 6); x29 -= l.x * x24; x29 -= l.y * x25; x29 -= l.z * x26; x29 -= l.w * x27; } { const v4f l = GDN_L4(29, 7); x29 -= l.x * x28; } __builtin_amdgcn_sched_barrier(0);
        float x30 = GDN_RHS(30); { const v4f l = GDN_L4(30, 0); x30 -= l.x * x0; x30 -= l.y * x1; x30 -= l.z * x2; x30 -= l.w * x3; } { const v4f l = GDN_L4(30, 1); x30 -= l.x * x4; x30 -= l.y * x5; x30 -= l.z * x6; x30 -= l.w * x7; } { const v4f l = GDN_L4(30, 2); x30 -= l.x * x8; x30 -= l.y * x9; x30 -= l.z * x10; x30 -= l.w * x11; } { const v4f l = GDN_L4(30, 3); x30 -= l.x * x12; x30 -= l.y * x13; x30 -= l.z * x14; x30 -= l.w * x15; } { const v4f l = GDN_L4(30, 4); x30 -= l.x * x16; x30 -= l.y * x17; x30 -= l.z * x18; x30 -= l.w * x19; } { const v4f l = GDN_L4(30, 5); x30 -= l.x * x20; x30 -= l.y * x21; x30 -= l.z * x22; x30 -= l.w * x23; } { const v4f l = GDN_L4(30, 6); x30 -= l.x * x24; x30 -= l.y * x25; x30 -= l.z * x26; x30 -= l.w * x27; } { const v4f l = GDN_L4(30, 7); x30 -= l.x * x28; x30 -= l.y * x29; } __builtin_amdgcn_sched_barrier(0);
        float x31 = GDN_RHS(31); { const v4f l = GDN_L4(31, 0); x31 -= l.x * x0; x31 -= l.y * x1; x31 -= l.z * x2; x31 -= l.w * x3; } { const v4f l = GDN_L4(31, 1); x31 -= l.x * x4; x31 -= l.y * x5; x31 -= l.z * x6; x31 -= l.w * x7; } { const v4f l = GDN_L4(31, 2); x31 -= l.x * x8; x31 -= l.y * x9; x31 -= l.z * x10; x31 -= l.w * x11; } { const v4f l = GDN_L4(31, 3); x31 -= l.x * x12; x31 -= l.y * x13; x31 -= l.z * x14; x31 -= l.w * x15; } { const v4f l = GDN_L4(31, 4); x31 -= l.x * x16; x31 -= l.y * x17; x31 -= l.z * x18; x31 -= l.w * x19; } { const v4f l = GDN_L4(31, 5); x31 -= l.x * x20; x31 -= l.y * x21; x31 -= l.z * x22; x31 -= l.w * x23; } { const v4f l = GDN_L4(31, 6); x31 -= l.x * x24; x31 -= l.y * x25; x31 -= l.z * x26; x31 -= l.w * x27; } { const v4f l = GDN_L4(31, 7); x31 -= l.x * x28; x31 -= l.y * x29; x31 -= l.z * x30; } __builtin_amdgcn_sched_barrier(0);
        float x32 = GDN_RHS(32); { const v4f l = GDN_L4(32, 0); x32 -= l.x * x0; x32 -= l.y * x1; x32 -= l.z * x2; x32 -= l.w * x3; } { const v4f l = GDN_L4(32, 1); x32 -= l.x * x4; x32 -= l.y * x5; x32 -= l.z * x6; x32 -= l.w * x7; } { const v4f l = GDN_L4(32, 2); x32 -= l.x * x8; x32 -= l.y * x9; x32 -= l.z * x10; x32 -= l.w * x11; } { const v4f l = GDN_L4(32, 3); x32 -= l.x * x12; x32 -= l.y * x13; x32 -= l.z * x14; x32 -= l.w * x15; } { const v4f l = GDN_L4(32, 4); x32 -= l.x * x16; x32 -= l.y * x17; x32 -= l.z * x18; x32 -= l.w * x19; } { const v4f l = GDN_L4(32, 5); x32 -= l.x * x20; x32 -= l.y * x21; x32 -= l.z * x22; x32 -= l.w * x23; } { const v4f l = GDN_L4(32, 6); x32 -= l.x * x24; x32 -= l.y * x25; x32 -= l.z * x26; x32 -= l.w * x27; } { const v4f l = GDN_L4(32, 7); x32 -= l.x * x28; x32 -= l.y * x29; x32 -= l.z * x30; x32 -= l.w * x31; } __builtin_amdgcn_sched_barrier(0);
        float x33 = GDN_RHS(33); { const v4f l = GDN_L4(33, 0); x33 -= l.x * x0; x33 -= l.y * x1; x33 -= l.z * x2; x33 -= l.w * x3; } { const v4f l = GDN_L4(33, 1); x33 -= l.x * x4; x33 -= l.y * x5; x33 -= l.z * x6; x33 -= l.w * x7; } { const v4f l = GDN_L4(33, 2); x33 -= l.x * x8; x33 -= l.y * x9; x33 -= l.z * x10; x33 -= l.w * x11; } { const v4f l = GDN_L4(33, 3); x33 -= l.x * x12; x33 -= l.y * x13; x33 -= l.z * x14; x33 -= l.w * x15; } { const v4f l = GDN_L4(33, 4); x33 -= l.x * x16; x33 -= l.y * x17; x33 -= l.z * x18; x33 -= l.w * x19; } { const v4f l = GDN_L4(33, 5); x33 -= l.x * x20; x33 -= l.y * x21; x33 -= l.z * x22; x33 -= l.w * x23; } { const v4f l = GDN_L4(33, 6); x33 -= l.x * x24; x33 -= l.y * x25; x33 -= l.z * x26; x33 -= l.w * x27; } { const v4f l = GDN_L4(33, 7); x33 -= l.x * x28; x33 -= l.y * x29; x33 -= l.z * x30; x33 -= l.w * x31; } { const v4f l = GDN_L4(33, 8); x33 -= l.x * x32; } __builtin_amdgcn_sched_barrier(0);
        float x34 = GDN_RHS(34); { const v4f l = GDN_L4(34, 0); x34 -= l.x * x0; x34 -= l.y * x1; x34 -= l.z * x2; x34 -= l.w * x3; } { const v4f l = GDN_L4(34, 1); x34 -= l.x * x4; x34 -= l.y * x5; x34 -= l.z * x6; x34 -= l.w * x7; } { const v4f l = GDN_L4(34, 2); x34 -= l.x * x8; x34 -= l.y * x9; x34 -= l.z * x10; x34 -= l.w * x11; } { const v4f l = GDN_L4(34, 3); x34 -= l.x * x12; x34 -= l.y * x13; x34 -= l.z * x14; x34 -= l.w * x15; } { const v4f l = GDN_L4(34, 4); x34 -= l.x * x16; x34 -= l.y * x17; x34 -= l.z * x18; x34 -= l.w * x19; } { const v4f l = GDN_L4(34, 5); x34 -= l.x * x20; x34 -= l.y * x21; x34 -= l.z * x22; x34 -= l.w * x23; } { const v4f l = GDN_L4(34, 6); x34 -= l.x * x24; x34 -= l.y * x25; x34 -= l.z * x26; x34 -= l.w * x27; } { const v4f l = GDN_L4(34, 7); x34 -= l.x * x28; x34 -= l.y * x29; x34 -= l.z * x30; x34 -= l.w * x31; } { const v4f l = GDN_L4(34, 8); x34 -= l.x * x32; x34 -= l.y * x33; } __builtin_amdgcn_sched_barrier(0);
        float x35 = GDN_RHS(35); { const v4f l = GDN_L4(35, 0); x35 -= l.x * x0; x35 -= l.y * x1; x35 -= l.z * x2; x35 -= l.w * x3; } { const v4f l = GDN_L4(35, 1); x35 -= l.x * x4; x35 -= l.y * x5; x35 -= l.z * x6; x35 -= l.w * x7; } { const v4f l = GDN_L4(35, 2); x35 -= l.x * x8; x35 -= l.y * x9; x35 -= l.z * x10; x35 -= l.w * x11; } { const v4f l = GDN_L4(35, 3); x35 -= l.x * x12; x35 -= l.y * x13; x35 -= l.z * x14; x35 -= l.w * x15; } { const v4f l = GDN_L4(35, 4); x35 -= l.x * x16; x35 -= l.y * x17; x35 -= l.z * x18; x35 -= l.w * x19; } { const v4f l = GDN_L4(35, 5); x35 -= l.x * x20; x35 -= l.y * x21; x35 -= l.z * x22; x35 -= l.w * x23; } { const v4f l = GDN_L4(35, 6); x35 -= l.x * x24; x35 -= l.y * x25; x35 -= l.z * x26; x35 -= l.w * x27; } { const v4f l = GDN_L4(35, 7); x35 -= l.x * x28; x35 -= l.y * x29; x35 -= l.z * x30; x35 -= l.w * x31; } { const v4f l = GDN_L4(35, 8); x35 -= l.x * x32; x35 -= l.y * x33; x35 -= l.z * x34; } __builtin_amdgcn_sched_barrier(0);
        float x36 = GDN_RHS(36); { const v4f l = GDN_L4(36, 0); x36 -= l.x * x0; x36 -= l.y * x1; x36 -= l.z * x2; x36 -= l.w * x3; } { const v4f l = GDN_L4(36, 1); x36 -= l.x * x4; x36 -= l.y * x5; x36 -= l.z * x6; x36 -= l.w * x7; } { const v4f l = GDN_L4(36, 2); x36 -= l.x * x8; x36 -= l.y * x9; x36 -= l.z * x10; x36 -= l.w * x11; } { const v4f l = GDN_L4(36, 3); x36 -= l.x * x12; x36 -= l.y * x13; x36 -= l.z * x14; x36 -= l.w * x15; } { const v4f l = GDN_L4(36, 4); x36 -= l.x * x16; x36 -= l.y * x17; x36 -= l.z * x18; x36 -= l.w * x19; } { const v4f l = GDN_L4(36, 5); x36 -= l.x * x20; x36 -= l.y * x21; x36 -= l.z * x22; x36 -= l.w * x23; } { const v4f l = GDN_L4(36, 6); x36 -= l.x * x24; x36 -= l.y * x25; x36 -= l.z * x26; x36 -= l.w * x27; } { const v4f l = GDN_L4(36, 7); x36 -= l.x * x28; x36 -= l.y * x29; x36 -= l.z * x30; x36 -= l.w * x31; } { const v4f l = GDN_L4(36, 8); x36 -= l.x * x32; x36 -= l.y * x33; x36 -= l.z * x34; x36 -= l.w * x35; } __builtin_amdgcn_sched_barrier(0);
        float x37 = GDN_RHS(37); { const v4f l = GDN_L4(37, 0); x37 -= l.x * x0; x37 -= l.y * x1; x37 -= l.z * x2; x37 -= l.w * x3; } { const v4f l = GDN_L4(37, 1); x37 -= l.x * x4; x37 -= l.y * x5; x37 -= l.z * x6; x37 -= l.w * x7; } { const v4f l = GDN_L4(37, 2); x37 -= l.x * x8; x37 -= l.y * x9; x37 -= l.z * x10; x37 -= l.w * x11; } { const v4f l = GDN_L4(37, 3); x37 -= l.x * x12; x37 -= l.y * x13; x37 -= l.z * x14; x37 -= l.w * x15; } { const v4f l = GDN_L4(37, 4); x37 -= l.x * x16; x37 -= l.y * x17; x37 -= l.z * x18; x37 -= l.w * x19; } { const v4f l = GDN_L4(37, 5); x37 -= l.x * x20; x37 -= l.y * x21; x37 -= l.z * x22; x37 -= l.w * x23; } { const v4f l = GDN_L4(37, 6); x37 -= l.x * x24; x37 -= l.y * x25; x37 -= l.z * x26; x37 -= l.w * x27; } { const v4f l = GDN_L4(37, 7); x37 -= l.x * x28; x37 -= l.y * x29; x37 -= l.z * x30; x37 -= l.w * x31; } { const v4f l = GDN_L4(37, 8); x37 -= l.x * x32; x37 -= l.y * x33; x37 -= l.z * x34; x37 -= l.w * x35; } { const v4f l = GDN_L4(37, 9); x37 -= l.x * x36; } __builtin_amdgcn_sched_barrier(0);
        float x38 = GDN_RHS(38); { const v4f l = GDN_L4(38, 0); x38 -= l.x * x0; x38 -= l.y * x1; x38 -= l.z * x2; x38 -= l.w * x3; } { const v4f l = GDN_L4(38, 1); x38 -= l.x * x4; x38 -= l.y * x5; x38 -= l.z * x6; x38 -= l.w * x7; } { const v4f l = GDN_L4(38, 2); x38 -= l.x * x8; x38 -= l.y * x9; x38 -= l.z * x10; x38 -= l.w * x11; } { const v4f l = GDN_L4(38, 3); x38 -= l.x * x12; x38 -= l.y * x13; x38 -= l.z * x14; x38 -= l.w * x15; } { const v4f l = GDN_L4(38, 4); x38 -= l.x * x16; x38 -= l.y * x17; x38 -= l.z * x18; x38 -= l.w * x19; } { const v4f l = GDN_L4(38, 5); x38 -= l.x * x20; x38 -= l.y * x21; x38 -= l.z * x22; x38 -= l.w * x23; } { const v4f l = GDN_L4(38, 6); x38 -= l.x * x24; x38 -= l.y * x25; x38 -= l.z * x26; x38 -= l.w * x27; } { const v4f l = GDN_L4(38, 7); x38 -= l.x * x28; x38 -= l.y * x29; x38 -= l.z * x30; x38 -= l.w * x31; } { const v4f l = GDN_L4(38, 8); x38 -= l.x * x32; x38 -= l.y * x33; x38 -= l.z * x34; x38 -= l.w * x35; } { const v4f l = GDN_L4(38, 9); x38 -= l.x * x36; x38 -= l.y * x37; } __builtin_amdgcn_sched_barrier(0);
        float x39 = GDN_RHS(39); { const v4f l = GDN_L4(39, 0); x39 -= l.x * x0; x39 -= l.y * x1; x39 -= l.z * x2; x39 -= l.w * x3; } { const v4f l = GDN_L4(39, 1); x39 -= l.x * x4; x39 -= l.y * x5; x39 -= l.z * x6; x39 -= l.w * x7; } { const v4f l = GDN_L4(39, 2); x39 -= l.x * x8; x39 -= l.y * x9; x39 -= l.z * x10; x39 -= l.w * x11; } { const v4f l = GDN_L4(39, 3); x39 -= l.x * x12; x39 -= l.y * x13; x39 -= l.z * x14; x39 -= l.w * x15; } { const v4f l = GDN_L4(39, 4); x39 -= l.x * x16; x39 -= l.y * x17; x39 -= l.z * x18; x39 -= l.w * x19; } { const v4f l = GDN_L4(39, 5); x39 -= l.x * x20; x39 -= l.y * x21; x39 -= l.z * x22; x39 -= l.w * x23; } { const v4f l = GDN_L4(39, 6); x39 -= l.x * x24; x39 -= l.y * x25; x39 -= l.z * x26; x39 -= l.w * x27; } { const v4f l = GDN_L4(39, 7); x39 -= l.x * x28; x39 -= l.y * x29; x39 -= l.z * x30; x39 -= l.w * x31; } { const v4f l = GDN_L4(39, 8); x39 -= l.x * x32; x39 -= l.y * x33; x39 -= l.z * x34; x39 -= l.w * x35; } { const v4f l = GDN_L4(39, 9); x39 -= l.x * x36; x39 -= l.y * x37; x39 -= l.z * x38; } __builtin_amdgcn_sched_barrier(0);
        float x40 = GDN_RHS(40); { const v4f l = GDN_L4(40, 0); x40 -= l.x * x0; x40 -= l.y * x1; x40 -= l.z * x2; x40 -= l.w * x3; } { const v4f l = GDN_L4(40, 1); x40 -= l.x * x4; x40 -= l.y * x5; x40 -= l.z * x6; x40 -= l.w * x7; } { const v4f l = GDN_L4(40, 2); x40 -= l.x * x8; x40 -= l.y * x9; x40 -= l.z * x10; x40 -= l.w * x11; } { const v4f l = GDN_L4(40, 3); x40 -= l.x * x12; x40 -= l.y * x13; x40 -= l.z * x14; x40 -= l.w * x15; } { const v4f l = GDN_L4(40, 4); x40 -= l.x * x16; x40 -= l.y * x17; x40 -= l.z * x18; x40 -= l.w * x19; } { const v4f l = GDN_L4(40, 5); x40 -= l.x * x20; x40 -= l.y * x21; x40 -= l.z * x22; x40 -= l.w * x23; } { const v4f l = GDN_L4(40, 6); x40 -= l.x * x24; x40 -= l.y * x25; x40 -= l.z * x26; x40 -= l.w * x27; } { const v4f l = GDN_L4(40, 7); x40 -= l.x * x28; x40 -= l.y * x29; x40 -= l.z * x30; x40 -= l.w * x31; } { const v4f l = GDN_L4(40, 8); x40 -= l.x * x32; x40 -= l.y * x33; x40 -= l.z * x34; x40 -= l.w * x35; } { const v4f l = GDN_L4(40, 9); x40 -= l.x * x36; x40 -= l.y * x37; x40 -= l.z * x38; x40 -= l.w * x39; } __builtin_amdgcn_sched_barrier(0);
        float x41 = GDN_RHS(41); { const v4f l = GDN_L4(41, 0); x41 -= l.x * x0; x41 -= l.y * x1; x41 -= l.z * x2; x41 -= l.w * x3; } { const v4f l = GDN_L4(41, 1); x41 -= l.x * x4; x41 -= l.y * x5; x41 -= l.z * x6; x41 -= l.w * x7; } { const v4f l = GDN_L4(41, 2); x41 -= l.x * x8; x41 -= l.y * x9; x41 -= l.z * x10; x41 -= l.w * x11; } { const v4f l = GDN_L4(41, 3); x41 -= l.x * x12; x41 -= l.y * x13; x41 -= l.z * x14; x41 -= l.w * x15; } { const v4f l = GDN_L4(41, 4); x41 -= l.x * x16; x41 -= l.y * x17; x41 -= l.z * x18; x41 -= l.w * x19; } { const v4f l = GDN_L4(41, 5); x41 -= l.x * x20; x41 -= l.y * x21; x41 -= l.z * x22; x41 -= l.w * x23; } { const v4f l = GDN_L4(41, 6); x41 -= l.x * x24; x41 -= l.y * x25; x41 -= l.z * x26; x41 -= l.w * x27; } { const v4f l = GDN_L4(41, 7); x41 -= l.x * x28; x41 -= l.y * x29; x41 -= l.z * x30; x41 -= l.w * x31; } { const v4f l = GDN_L4(41, 8); x41 -= l.x * x32; x41 -= l.y * x33; x41 -= l.z * x34; x41 -= l.w * x35; } { const v4f l = GDN_L4(41, 9); x41 -= l.x * x36; x41 -= l.y * x37; x41 -= l.z * x38; x41 -= l.w * x39; } { const v4f l = GDN_L4(41, 10); x41 -= l.x * x40; } __builtin_amdgcn_sched_barrier(0);
        float x42 = GDN_RHS(42); { const v4f l = GDN_L4(42, 0); x42 -= l.x * x0; x42 -= l.y * x1; x42 -= l.z * x2; x42 -= l.w * x3; } { const v4f l = GDN_L4(42, 1); x42 -= l.x * x4; x42 -= l.y * x5; x42 -= l.z * x6; x42 -= l.w * x7; } { const v4f l = GDN_L4(42, 2); x42 -= l.x * x8; x42 -= l.y * x9; x42 -= l.z * x10; x42 -= l.w * x11; } { const v4f l = GDN_L4(42, 3); x42 -= l.x * x12; x42 -= l.y * x13; x42 -= l.z * x14; x42 -= l.w * x15; } { const v4f l = GDN_L4(42, 4); x42 -= l.x * x16; x42 -= l.y * x17; x42 -= l.z * x18; x42 -= l.w * x19; } { const v4f l = GDN_L4(42, 5); x42 -= l.x * x20; x42 -= l.y * x21; x42 -= l.z * x22; x42 -= l.w * x23; } { const v4f l = GDN_L4(42, 6); x42 -= l.x * x24; x42 -= l.y * x25; x42 -= l.z * x26; x42 -= l.w * x27; } { const v4f l = GDN_L4(42, 7); x42 -= l.x * x28; x42 -= l.y * x29; x42 -= l.z * x30; x42 -= l.w * x31; } { const v4f l = GDN_L4(42, 8); x42 -= l.x * x32; x42 -= l.y * x33; x42 -= l.z * x34; x42 -= l.w * x35; } { const v4f l = GDN_L4(42, 9); x42 -= l.x * x36; x42 -= l.y * x37; x42 -= l.z * x38; x42 -= l.w * x39; } { const v4f l = GDN_L4(42, 10); x42 -= l.x * x40; x42 -= l.y * x41; } __builtin_amdgcn_sched_barrier(0);
        float x43 = GDN_RHS(43); { const v4f l = GDN_L4(43, 0); x43 -= l.x * x0; x43 -= l.y * x1; x43 -= l.z * x2; x43 -= l.w * x3; } { const v4f l = GDN_L4(43, 1); x43 -= l.x * x4; x43 -= l.y * x5; x43 -= l.z * x6; x43 -= l.w * x7; } { const v4f l = GDN_L4(43, 2); x43 -= l.x * x8; x43 -= l.y * x9; x43 -= l.z * x10; x43 -= l.w * x11; } { const v4f l = GDN_L4(43, 3); x43 -= l.x * x12; x43 -= l.y * x13; x43 -= l.z * x14; x43 -= l.w * x15; } { const v4f l = GDN_L4(43, 4); x43 -= l.x * x16; x43 -= l.y * x17; x43 -= l.z * x18; x43 -= l.w * x19; } { const v4f l = GDN_L4(43, 5); x43 -= l.x * x20; x43 -= l.y * x21; x43 -= l.z * x22; x43 -= l.w * x23; } { const v4f l = GDN_L4(43, 6); x43 -= l.x * x24; x43 -= l.y * x25; x43 -= l.z * x26; x43 -= l.w * x27; } { const v4f l = GDN_L4(43, 7); x43 -= l.x * x28; x43 -= l.y * x29; x43 -= l.z * x30; x43 -= l.w * x31; } { const v4f l = GDN_L4(43, 8); x43 -= l.x * x32; x43 -= l.y * x33; x43 -= l.z * x34; x43 -= l.w * x35; } { const v4f l = GDN_L4(43, 9); x43 -= l.x * x36; x43 -= l.y * x37; x43 -= l.z * x38; x43 -= l.w * x39; } { const v4f l = GDN_L4(43, 10); x43 -= l.x * x40; x43 -= l.y * x41; x43 -= l.z * x42; } __builtin_amdgcn_sched_barrier(0);
        float x44 = GDN_RHS(44); { const v4f l = GDN_L4(44, 0); x44 -= l.x * x0; x44 -= l.y * x1; x44 -= l.z * x2; x44 -= l.w * x3; } { const v4f l = GDN_L4(44, 1); x44 -= l.x * x4; x44 -= l.y * x5; x44 -= l.z * x6; x44 -= l.w * x7; } { const v4f l = GDN_L4(44, 2); x44 -= l.x * x8; x44 -= l.y * x9; x44 -= l.z * x10; x44 -= l.w * x11; } { const v4f l = GDN_L4(44, 3); x44 -= l.x * x12; x44 -= l.y * x13; x44 -= l.z * x14; x44 -= l.w * x15; } { const v4f l = GDN_L4(44, 4); x44 -= l.x * x16; x44 -= l.y * x17; x44 -= l.z * x18; x44 -= l.w * x19; } { const v4f l = GDN_L4(44, 5); x44 -= l.x * x20; x44 -= l.y * x21; x44 -= l.z * x22; x44 -= l.w * x23; } { const v4f l = GDN_L4(44, 6); x44 -= l.x * x24; x44 -= l.y * x25; x44 -= l.z * x26; x44 -= l.w * x27; } { const v4f l = GDN_L4(44, 7); x44 -= l.x * x28; x44 -= l.y * x29; x44 -= l.z * x30; x44 -= l.w * x31; } { const v4f l = GDN_L4(44, 8); x44 -= l.x * x32; x44 -= l.y * x33; x44 -= l.z * x34; x44 -= l.w * x35; } { const v4f l = GDN_L4(44, 9); x44 -= l.x * x36; x44 -= l.y * x37; x44 -= l.z * x38; x44 -= l.w * x39; } { const v4f l = GDN_L4(44, 10); x44 -= l.x * x40; x44 -= l.y * x41; x44 -= l.z * x42; x44 -= l.w * x43; } __builtin_amdgcn_sched_barrier(0);
        float x45 = GDN_RHS(45); { const v4f l = GDN_L4(45, 0); x45 -= l.x * x0; x45 -= l.y * x1; x45 -= l.z * x2; x45 -= l.w * x3; } { const v4f l = GDN_L4(45, 1); x45 -= l.x * x4; x45 -= l.y * x5; x45 -= l.z * x6; x45 -= l.w * x7; } { const v4f l = GDN_L4(45, 2); x45 -= l.x * x8; x45 -= l.y * x9; x45 -= l.z * x10; x45 -= l.w * x11; } { const v4f l = GDN_L4(45, 3); x45 -= l.x * x12; x45 -= l.y * x13; x45 -= l.z * x14; x45 -= l.w * x15; } { const v4f l = GDN_L4(45, 4); x45 -= l.x * x16; x45 -= l.y * x17; x45 -= l.z * x18; x45 -= l.w * x19; } { const v4f l = GDN_L4(45, 5); x45 -= l.x * x20; x45 -= l.y * x21; x45 -= l.z * x22; x45 -= l.w * x23; } { const v4f l = GDN_L4(45, 6); x45 -= l.x * x24; x45 -= l.y * x25; x45 -= l.z * x26; x45 -= l.w * x27; } { const v4f l = GDN_L4(45, 7); x45 -= l.x * x28; x45 -= l.y * x29; x45 -= l.z * x30; x45 -= l.w * x31; } { const v4f l = GDN_L4(45, 8); x45 -= l.x * x32; x45 -= l.y * x33; x45 -= l.z * x34; x45 -= l.w * x35; } { const v4f l = GDN_L4(45, 9); x45 -= l.x * x36; x45 -= l.y * x37; x45 -= l.z * x38; x45 -= l.w * x39; } { const v4f l = GDN_L4(45, 10); x45 -= l.x * x40; x45 -= l.y * x41; x45 -= l.z * x42; x45 -= l.w * x43; } { const v4f l = GDN_L4(45, 11); x45 -= l.x * x44; } __builtin_amdgcn_sched_barrier(0);
        float x46 = GDN_RHS(46); { const v4f l = GDN_L4(46, 0); x46 -= l.x * x0; x46 -= l.y * x1; x46 -= l.z * x2; x46 -= l.w * x3; } { const v4f l = GDN_L4(46, 1); x46 -= l.x * x4; x46 -= l.y * x5; x46 -= l.z * x6; x46 -= l.w * x7; } { const v4f l = GDN_L4(46, 2); x46 -= l.x * x8; x46 -= l.y * x9; x46 -= l.z * x10; x46 -= l.w * x11; } { const v4f l = GDN_L4(46, 3); x46 -= l.x * x12; x46 -= l.y * x13; x46 -= l.z * x14; x46 -= l.w * x15; } { const v4f l = GDN_L4(46, 4); x46 -= l.x * x16; x46 -= l.y * x17; x46 -= l.z * x18; x46 -= l.w * x19; } { const v4f l = GDN_L4(46, 5); x46 -= l.x * x20; x46 -= l.y * x21; x46 -= l.z * x22; x46 -= l.w * x23; } { const v4f l = GDN_L4(46, 6); x46 -= l.x * x24; x46 -= l.y * x25; x46 -= l.z * x26; x46 -= l.w * x27; } { const v4f l = GDN_L4(46, 7); x46 -= l.x * x28; x46 -= l.y * x29; x46 -= l.z * x30; x46 -= l.w * x31; } { const v4f l = GDN_L4(46, 8); x46 -= l.x * x32; x46 -= l.y * x33; x46 -= l.z * x34; x46 -= l.w * x35; } { const v4f l = GDN_L4(46, 9); x46 -= l.x * x36; x46 -= l.y * x37; x46 -= l.z * x38; x46 -= l.w * x39; } { const v4f l = GDN_L4(46, 10); x46 -= l.x * x40; x46 -= l.y * x41; x46 -= l.z * x42; x46 -= l.w * x43; } { const v4f l = GDN_L4(46, 11); x46 -= l.x * x44; x46 -= l.y * x45; } __builtin_amdgcn_sched_barrier(0);
        float x47 = GDN_RHS(47); { const v4f l = GDN_L4(47, 0); x47 -= l.x * x0; x47 -= l.y * x1; x47 -= l.z * x2; x47 -= l.w * x3; } { const v4f l = GDN_L4(47, 1); x47 -= l.x * x4; x47 -= l.y * x5; x47 -= l.z * x6; x47 -= l.w * x7; } { const v4f l = GDN_L4(47, 2); x47 -= l.x * x8; x47 -= l.y * x9; x47 -= l.z * x10; x47 -= l.w * x11; } { const v4f l = GDN_L4(47, 3); x47 -= l.x * x12; x47 -= l.y * x13; x47 -= l.z * x14; x47 -= l.w * x15; } { const v4f l = GDN_L4(47, 4); x47 -= l.x * x16; x47 -= l.y * x17; x47 -= l.z * x18; x47 -= l.w * x19; } { const v4f l = GDN_L4(47, 5); x47 -= l.x * x20; x47 -= l.y * x21; x47 -= l.z * x22; x47 -= l.w * x23; } { const v4f l = GDN_L4(47, 6); x47 -= l.x * x24; x47 -= l.y * x25; x47 -= l.z * x26; x47 -= l.w * x27; } { const v4f l = GDN_L4(47, 7); x47 -= l.x * x28; x47 -= l.y * x29; x47 -= l.z * x30; x47 -= l.w * x31; } { const v4f l = GDN_L4(47, 8); x47 -= l.x * x32; x47 -= l.y * x33; x47 -= l.z * x34; x47 -= l.w * x35; } { const v4f l = GDN_L4(47, 9); x47 -= l.x * x36; x47 -= l.y * x37; x47 -= l.z * x38; x47 -= l.w * x39; } { const v4f l = GDN_L4(47, 10); x47 -= l.x * x40; x47 -= l.y * x41; x47 -= l.z * x42; x47 -= l.w * x43; } { const v4f l = GDN_L4(47, 11); x47 -= l.x * x44; x47 -= l.y * x45; x47 -= l.z * x46; } __builtin_amdgcn_sched_barrier(0);
        float x48 = GDN_RHS(48); { const v4f l = GDN_L4(48, 0); x48 -= l.x * x0; x48 -= l.y * x1; x48 -= l.z * x2; x48 -= l.w * x3; } { const v4f l = GDN_L4(48, 1); x48 -= l.x * x4; x48 -= l.y * x5; x48 -= l.z * x6; x48 -= l.w * x7; } { const v4f l = GDN_L4(48, 2); x48 -= l.x * x8; x48 -= l.y * x9; x48 -= l.z * x10; x48 -= l.w * x11; } { const v4f l = GDN_L4(48, 3); x48 -= l.x * x12; x48 -= l.y * x13; x48 -= l.z * x14; x48 -= l.w * x15; } { const v4f l = GDN_L4(48, 4); x48 -= l.x * x16; x48 -= l.y * x17; x48 -= l.z * x18; x48 -= l.w * x19; } { const v4f l = GDN_L4(48, 5); x48 -= l.x * x20; x48 -= l.y * x21; x48 -= l.z * x22; x48 -= l.w * x23; } { const v4f l = GDN_L4(48, 6); x48 -= l.x * x24; x48 -= l.y * x25; x48 -= l.z * x26; x48 -= l.w * x27; } { const v4f l = GDN_L4(48, 7); x48 -= l.x * x28; x48 -= l.y * x29; x48 -= l.z * x30; x48 -= l.w * x31; } { const v4f l = GDN_L4(48, 8); x48 -= l.x * x32; x48 -= l.y * x33; x48 -= l.z * x34; x48 -= l.w * x35; } { const v4f l = GDN_L4(48, 9); x48 -= l.x * x36; x48 -= l.y * x37; x48 -= l.z * x38; x48 -= l.w * x39; } { const v4f l = GDN_L4(48, 10); x48 -= l.x * x40; x48 -= l.y * x41; x48 -= l.z * x42; x48 -= l.w * x43; } { const v4f l = GDN_L4(48, 11); x48 -= l.x * x44; x48 -= l.y * x45; x48 -= l.z * x46; x48 -= l.w * x47; } __builtin_amdgcn_sched_barrier(0);
        float x49 = GDN_RHS(49); { const v4f l = GDN_L4(49, 0); x49 -= l.x * x0; x49 -= l.y * x1; x49 -= l.z * x2; x49 -= l.w * x3; } { const v4f l = GDN_L4(49, 1); x49 -= l.x * x4; x49 -= l.y * x5; x49 -= l.z * x6; x49 -= l.w * x7; } { const v4f l = GDN_L4(49, 2); x49 -= l.x * x8; x49 -= l.y * x9; x49 -= l.z * x10; x49 -= l.w * x11; } { const v4f l = GDN_L4(49, 3); x49 -= l.x * x12; x49 -= l.y * x13; x49 -= l.z * x14; x49 -= l.w * x15; } { const v4f l = GDN_L4(49, 4); x49 -= l.x * x16; x49 -= l.y * x17; x49 -= l.z * x18; x49 -= l.w * x19; } { const v4f l = GDN_L4(49, 5); x49 -= l.x * x20; x49 -= l.y * x21; x49 -= l.z * x22; x49 -= l.w * x23; } { const v4f l = GDN_L4(49, 6); x49 -= l.x * x24; x49 -= l.y * x25; x49 -= l.z * x26; x49 -= l.w * x27; } { const v4f l = GDN_L4(49, 7); x49 -= l.x * x28; x49 -= l.y * x29; x49 -= l.z * x30; x49 -= l.w * x31; } { const v4f l = GDN_L4(49, 8); x49 -= l.x * x32; x49 -= l.y * x33; x49 -= l.z * x34; x49 -= l.w * x35; } { const v4f l = GDN_L4(49, 9); x49 -= l.x * x36; x49 -= l.y * x37; x49 -= l.z * x38; x49 -= l.w * x39; } { const v4f l = GDN_L4(49, 10); x49 -= l.x * x40; x49 -= l.y * x41; x49 -= l.z * x42; x49 -= l.w * x43; } { const v4f l = GDN_L4(49, 11); x49 -= l.x * x44; x49 -= l.y * x45; x49 -= l.z * x46; x49 -= l.w * x47; } { const v4f l = GDN_L4(49, 12); x49 -= l.x * x48; } __builtin_amdgcn_sched_barrier(0);
        float x50 = GDN_RHS(50); { const v4f l = GDN_L4(50, 0); x50 -= l.x * x0; x50 -= l.y * x1; x50 -= l.z * x2; x50 -= l.w * x3; } { const v4f l = GDN_L4(50, 1); x50 -= l.x * x4; x50 -= l.y * x5; x50 -= l.z * x6; x50 -= l.w * x7; } { const v4f l = GDN_L4(50, 2); x50 -= l.x * x8; x50 -= l.y * x9; x50 -= l.z * x10; x50 -= l.w * x11; } { const v4f l = GDN_L4(50, 3); x50 -= l.x * x12; x50 -= l.y * x13; x50 -= l.z * x14; x50 -= l.w * x15; } { const v4f l = GDN_L4(50, 4); x50 -= l.x * x16; x50 -= l.y * x17; x50 -= l.z * x18; x50 -= l.w * x19; } { const v4f l = GDN_L4(50, 5); x50 -= l.x * x20; x50 -= l.y * x21; x50 -= l.z * x22; x50 -= l.w * x23; } { const v4f l = GDN_L4(50, 6); x50 -= l.x * x24; x50 -= l.y * x25; x50 -= l.z * x26; x50 -= l.w * x27; } { const v4f l = GDN_L4(50, 7); x50 -= l.x * x28; x50 -= l.y * x29; x50 -= l.z * x30; x50 -= l.w * x31; } { const v4f l = GDN_L4(50, 8); x50 -= l.x * x32; x50 -= l.y * x33; x50 -= l.z * x34; x50 -= l.w * x35; } { const v4f l = GDN_L4(50, 9); x50 -= l.x * x36; x50 -= l.y * x37; x50 -= l.z * x38; x50 -= l.w * x39; } { const v4f l = GDN_L4(50, 10); x50 -= l.x * x40; x50 -= l.y * x41; x50 -= l.z * x42; x50 -= l.w * x43; } { const v4f l = GDN_L4(50, 11); x50 -= l.x * x44; x50 -= l.y * x45; x50 -= l.z * x46; x50 -= l.w * x47; } { const v4f l = GDN_L4(50, 12); x50 -= l.x * x48; x50 -= l.y * x49; } __builtin_amdgcn_sched_barrier(0);
        float x51 = GDN_RHS(51); { const v4f l = GDN_L4(51, 0); x51 -= l.x * x0; x51 -= l.y * x1; x51 -= l.z * x2; x51 -= l.w * x3; } { const v4f l = GDN_L4(51, 1); x51 -= l.x * x4; x51 -= l.y * x5; x51 -= l.z * x6; x51 -= l.w * x7; } { const v4f l = GDN_L4(51, 2); x51 -= l.x * x8; x51 -= l.y * x9; x51 -= l.z * x10; x51 -= l.w * x11; } { const v4f l = GDN_L4(51, 3); x51 -= l.x * x12; x51 -= l.y * x13; x51 -= l.z * x14; x51 -= l.w * x15; } { const v4f l = GDN_L4(51, 4); x51 -= l.x * x16; x51 -= l.y * x17; x51 -= l.z * x18; x51 -= l.w * x19; } { const v4f l = GDN_L4(51, 5); x51 -= l.x * x20; x51 -= l.y * x21; x51 -= l.z * x22; x51 -= l.w * x23; } { const v4f l = GDN_L4(51, 6); x51 -= l.x * x24; x51 -= l.y * x25; x51 -= l.z * x26; x51 -= l.w * x27; } { const v4f l = GDN_L4(51, 7); x51 -= l.x * x28; x51 -= l.y * x29; x51 -= l.z * x30; x51 -= l.w * x31; } { const v4f l = GDN_L4(51, 8); x51 -= l.x * x32; x51 -= l.y * x33; x51 -= l.z * x34; x51 -= l.w * x35; } { const v4f l = GDN_L4(51, 9); x51 -= l.x * x36; x51 -= l.y * x37; x51 -= l.z * x38; x51 -= l.w * x39; } { const v4f l = GDN_L4(51, 10); x51 -= l.x * x40; x51 -= l.y * x41; x51 -= l.z * x42; x51 -= l.w * x43; } { const v4f l = GDN_L4(51, 11); x51 -= l.x * x44; x51 -= l.y * x45; x51 -= l.z * x46; x51 -= l.w * x47; } { const v4f l = GDN_L4(51, 12); x51 -= l.x * x48; x51 -= l.y * x49; x51 -= l.z * x50; } __builtin_amdgcn_sched_barrier(0);
        float x52 = GDN_RHS(52); { const v4f l = GDN_L4(52, 0); x52 -= l.x * x0; x52 -= l.y * x1; x52 -= l.z * x2; x52 -= l.w * x3; } { const v4f l = GDN_L4(52, 1); x52 -= l.x * x4; x52 -= l.y * x5; x52 -= l.z * x6; x52 -= l.w * x7; } { const v4f l = GDN_L4(52, 2); x52 -= l.x * x8; x52 -= l.y * x9; x52 -= l.z * x10; x52 -= l.w * x11; } { const v4f l = GDN_L4(52, 3); x52 -= l.x * x12; x52 -= l.y * x13; x52 -= l.z * x14; x52 -= l.w * x15; } { const v4f l = GDN_L4(52, 4); x52 -= l.x * x16; x52 -= l.y * x17; x52 -= l.z * x18; x52 -= l.w * x19; } { const v4f l = GDN_L4(52, 5); x52 -= l.x * x20; x52 -= l.y * x21; x52 -= l.z * x22; x52 -= l.w * x23; } { const v4f l = GDN_L4(52, 6); x52 -= l.x * x24; x52 -= l.y * x25; x52 -= l.z * x26; x52 -= l.w * x27; } { const v4f l = GDN_L4(52, 7); x52 -= l.x * x28; x52 -= l.y * x29; x52 -= l.z * x30; x52 -= l.w * x31; } { const v4f l = GDN_L4(52, 8); x52 -= l.x * x32; x52 -= l.y * x33; x52 -= l.z * x34; x52 -= l.w * x35; } { const v4f l = GDN_L4(52, 9); x52 -= l.x * x36; x52 -= l.y * x37; x52 -= l.z * x38; x52 -= l.w * x39; } { const v4f l = GDN_L4(52, 10); x52 -= l.x * x40; x52 -= l.y * x41; x52 -= l.z * x42; x52 -= l.w * x43; } { const v4f l = GDN_L4(52, 11); x52 -= l.x * x44; x52 -= l.y * x45; x52 -= l.z * x46; x52 -= l.w * x47; } { const v4f l = GDN_L4(52, 12); x52 -= l.x * x48; x52 -= l.y * x49; x52 -= l.z * x50; x52 -= l.w * x51; } __builtin_amdgcn_sched_barrier(0);
        float x53 = GDN_RHS(53); { const v4f l = GDN_L4(53, 0); x53 -= l.x * x0; x53 -= l.y * x1; x53 -= l.z * x2; x53 -= l.w * x3; } { const v4f l = GDN_L4(53, 1); x53 -= l.x * x4; x53 -= l.y * x5; x53 -= l.z * x6; x53 -= l.w * x7; } { const v4f l = GDN_L4(53, 2); x53 -= l.x * x8; x53 -= l.y * x9; x53 -= l.z * x10; x53 -= l.w * x11; } { const v4f l = GDN_L4(53, 3); x53 -= l.x * x12; x53 -= l.y * x13; x53 -= l.z * x14; x53 -= l.w * x15; } { const v4f l = GDN_L4(53, 4); x53 -= l.x * x16; x53 -= l.y * x17; x53 -= l.z * x18; x53 -= l.w * x19; } { const v4f l = GDN_L4(53, 5); x53 -= l.x * x20; x53 -= l.y * x21; x53 -= l.z * x22; x53 -= l.w * x23; } { const v4f l = GDN_L4(53, 6); x53 -= l.x * x24; x53 -= l.y * x25; x53 -= l.z * x26; x53 -= l.w * x27; } { const v4f l = GDN_L4(53, 7); x53 -= l.x * x28; x53 -= l.y * x29; x53 -= l.z * x30; x53 -= l.w * x31; } { const v4f l = GDN_L4(53, 8); x53 -= l.x * x32; x53 -= l.y * x33; x53 -= l.z * x34; x53 -= l.w * x35; } { const v4f l = GDN_L4(53, 9); x53 -= l.x * x36; x53 -= l.y * x37; x53 -= l.z * x38; x53 -= l.w * x39; } { const v4f l = GDN_L4(53, 10); x53 -= l.x * x40; x53 -= l.y * x41; x53 -= l.z * x42; x53 -= l.w * x43; } { const v4f l = GDN_L4(53, 11); x53 -= l.x * x44; x53 -= l.y * x45; x53 -= l.z * x46; x53 -= l.w * x47; } { const v4f l = GDN_L4(53, 12); x53 -= l.x * x48; x53 -= l.y * x49; x53 -= l.z * x50; x53 -= l.w * x51; } { const v4f l = GDN_L4(53, 13); x53 -= l.x * x52; } __builtin_amdgcn_sched_barrier(0);
        float x54 = GDN_RHS(54); { const v4f l = GDN_L4(54, 0); x54 -= l.x * x0; x54 -= l.y * x1; x54 -= l.z * x2; x54 -= l.w * x3; } { const v4f l = GDN_L4(54, 1); x54 -= l.x * x4; x54 -= l.y * x5; x54 -= l.z * x6; x54 -= l.w * x7; } { const v4f l = GDN_L4(54, 2); x54 -= l.x * x8; x54 -= l.y * x9; x54 -= l.z * x10; x54 -= l.w * x11; } { const v4f l = GDN_L4(54, 3); x54 -= l.x * x12; x54 -= l.y * x13; x54 -= l.z * x14; x54 -= l.w * x15; } { const v4f l = GDN_L4(54, 4); x54 -= l.x * x16; x54 -= l.y * x17; x54 -= l.z * x18; x54 -= l.w * x19; } { const v4f l = GDN_L4(54, 5); x54 -= l.x * x20; x54 -= l.y * x21; x54 -= l.z * x22; x54 -= l.w * x23; } { const v4f l = GDN_L4(54, 6); x54 -= l.x * x24; x54 -= l.y * x25; x54 -= l.z * x26; x54 -= l.w * x27; } { const v4f l = GDN_L4(54, 7); x54 -= l.x * x28; x54 -= l.y * x29; x54 -= l.z * x30; x54 -= l.w * x31; } { const v4f l = GDN_L4(54, 8); x54 -= l.x * x32; x54 -= l.y * x33; x54 -= l.z * x34; x54 -= l.w * x35; } { const v4f l = GDN_L4(54, 9); x54 -= l.x * x36; x54 -= l.y * x37; x54 -= l.z * x38; x54 -= l.w * x39; } { const v4f l = GDN_L4(54, 10); x54 -= l.x * x40; x54 -= l.y * x41; x54 -= l.z * x42; x54 -= l.w * x43; } { const v4f l = GDN_L4(54, 11); x54 -= l.x * x44; x54 -= l.y * x45; x54 -= l.z * x46; x54 -= l.w * x47; } { const v4f l = GDN_L4(54, 12); x54 -= l.x * x48; x54 -= l.y * x49; x54 -= l.z * x50; x54 -= l.w * x51; } { const v4f l = GDN_L4(54, 13); x54 -= l.x * x52; x54 -= l.y * x53; } __builtin_amdgcn_sched_barrier(0);
        float x55 = GDN_RHS(55); { const v4f l = GDN_L4(55, 0); x55 -= l.x * x0; x55 -= l.y * x1; x55 -= l.z * x2; x55 -= l.w * x3; } { const v4f l = GDN_L4(55, 1); x55 -= l.x * x4; x55 -= l.y * x5; x55 -= l.z * x6; x55 -= l.w * x7; } { const v4f l = GDN_L4(55, 2); x55 -= l.x * x8; x55 -= l.y * x9; x55 -= l.z * x10; x55 -= l.w * x11; } { const v4f l = GDN_L4(55, 3); x55 -= l.x * x12; x55 -= l.y * x13; x55 -= l.z * x14; x55 -= l.w * x15; } { const v4f l = GDN_L4(55, 4); x55 -= l.x * x16; x55 -= l.y * x17; x55 -= l.z * x18; x55 -= l.w * x19; } { const v4f l = GDN_L4(55, 5); x55 -= l.x * x20; x55 -= l.y * x21; x55 -= l.z * x22; x55 -= l.w * x23; } { const v4f l = GDN_L4(55, 6); x55 -= l.x * x24; x55 -= l.y * x25; x55 -= l.z * x26; x55 -= l.w * x27; } { const v4f l = GDN_L4(55, 7); x55 -= l.x * x28; x55 -= l.y * x29; x55 -= l.z * x30; x55 -= l.w * x31; } { const v4f l = GDN_L4(55, 8); x55 -= l.x * x32; x55 -= l.y * x33; x55 -= l.z * x34; x55 -= l.w * x35; } { const v4f l = GDN_L4(55, 9); x55 -= l.x * x36; x55 -= l.y * x37; x55 -= l.z * x38; x55 -= l.w * x39; } { const v4f l = GDN_L4(55, 10); x55 -= l.x * x40; x55 -= l.y * x41; x55 -= l.z * x42; x55 -= l.w * x43; } { const v4f l = GDN_L4(55, 11); x55 -= l.x * x44; x55 -= l.y * x45; x55 -= l.z * x46; x55 -= l.w * x47; } { const v4f l = GDN_L4(55, 12); x55 -= l.x * x48; x55 -= l.y * x49; x55 -= l.z * x50; x55 -= l.w * x51; } { const v4f l = GDN_L4(55, 13); x55 -= l.x * x52; x55 -= l.y * x53; x55 -= l.z * x54; } __builtin_amdgcn_sched_barrier(0);
        float x56 = GDN_RHS(56); { const v4f l = GDN_L4(56, 0); x56 -= l.x * x0; x56 -= l.y * x1; x56 -= l.z * x2; x56 -= l.w * x3; } { const v4f l = GDN_L4(56, 1); x56 -= l.x * x4; x56 -= l.y * x5; x56 -= l.z * x6; x56 -= l.w * x7; } { const v4f l = GDN_L4(56, 2); x56 -= l.x * x8; x56 -= l.y * x9; x56 -= l.z * x10; x56 -= l.w * x11; } { const v4f l = GDN_L4(56, 3); x56 -= l.x * x12; x56 -= l.y * x13; x56 -= l.z * x14; x56 -= l.w * x15; } { const v4f l = GDN_L4(56, 4); x56 -= l.x * x16; x56 -= l.y * x17; x56 -= l.z * x18; x56 -= l.w * x19; } { const v4f l = GDN_L4(56, 5); x56 -= l.x * x20; x56 -= l.y * x21; x56 -= l.z * x22; x56 -= l.w * x23; } { const v4f l = GDN_L4(56, 6); x56 -= l.x * x24; x56 -= l.y * x25; x56 -= l.z * x26; x56 -= l.w * x27; } { const v4f l = GDN_L4(56, 7); x56 -= l.x * x28; x56 -= l.y * x29; x56 -= l.z * x30; x56 -= l.w * x31; } { const v4f l = GDN_L4(56, 8); x56 -= l.x * x32; x56 -= l.y * x33; x56 -= l.z * x34; x56 -= l.w * x35; } { const v4f l = GDN_L4(56, 9); x56 -= l.x * x36; x56 -= l.y * x37; x56 -= l.z * x38; x56 -= l.w * x39; } { const v4f l = GDN_L4(56, 10); x56 -= l.x * x40; x56 -= l.y * x41; x56 -= l.z * x42; x56 -= l.w * x43; } { const v4f l = GDN_L4(56, 11); x56 -= l.x * x44; x56 -= l.y * x45; x56 -= l.z * x46; x56 -= l.w * x47; } { const v4f l = GDN_L4(56, 12); x56 -= l.x * x48; x56 -= l.y * x49; x56 -= l.z * x50; x56 -= l.w * x51; } { const v4f l = GDN_L4(56, 13); x56 -= l.x * x52; x56 -= l.y * x53; x56 -= l.z * x54; x56 -= l.w * x55; } __builtin_amdgcn_sched_barrier(0);
        float x57 = GDN_RHS(57); { const v4f l = GDN_L4(57, 0); x57 -= l.x * x0; x57 -= l.y * x1; x57 -= l.z * x2; x57 -= l.w * x3; } { const v4f l = GDN_L4(57, 1); x57 -= l.x * x4; x57 -= l.y * x5; x57 -= l.z * x6; x57 -= l.w * x7; } { const v4f l = GDN_L4(57, 2); x57 -= l.x * x8; x57 -= l.y * x9; x57 -= l.z * x10; x57 -= l.w * x11; } { const v4f l = GDN_L4(57, 3); x57 -= l.x * x12; x57 -= l.y * x13; x57 -= l.z * x14; x57 -= l.w * x15; } { const v4f l = GDN_L4(57, 4); x57 -= l.x * x16; x57 -= l.y * x17; x57 -= l.z * x18; x57 -= l.w * x19; } { const v4f l = GDN_L4(57, 5); x57 -= l.x * x20; x57 -= l.y * x21; x57 -= l.z * x22; x57 -= l.w * x23; } { const v4f l = GDN_L4(57, 6); x57 -= l.x * x24; x57 -= l.y * x25; x57 -= l.z * x26; x57 -= l.w * x27; } { const v4f l = GDN_L4(57, 7); x57 -= l.x * x28; x57 -= l.y * x29; x57 -= l.z * x30; x57 -= l.w * x31; } { const v4f l = GDN_L4(57, 8); x57 -= l.x * x32; x57 -= l.y * x33; x57 -= l.z * x34; x57 -= l.w * x35; } { const v4f l = GDN_L4(57, 9); x57 -= l.x * x36; x57 -= l.y * x37; x57 -= l.z * x38; x57 -= l.w * x39; } { const v4f l = GDN_L4(57, 10); x57 -= l.x * x40; x57 -= l.y * x41; x57 -= l.z * x42; x57 -= l.w * x43; } { const v4f l = GDN_L4(57, 11); x57 -= l.x * x44; x57 -= l.y * x45; x57 -= l.z * x46; x57 -= l.w * x47; } { const v4f l = GDN_L4(57, 12); x57 -= l.x * x48; x57 -= l.y * x49; x57 -= l.z * x50; x57 -= l.w * x51; } { const v4f l = GDN_L4(57, 13); x57 -= l.x * x52; x57 -= l.y * x53; x57 -= l.z * x54; x57 -= l.w * x55; } { const v4f l = GDN_L4(57, 14); x57 -= l.x * x56; } __builtin_amdgcn_sched_barrier(0);
        float x58 = GDN_RHS(58); { const v4f l = GDN_L4(58, 0); x58 -= l.x * x0; x58 -= l.y * x1; x58 -= l.z * x2; x58 -= l.w * x3; } { const v4f l = GDN_L4(58, 1); x58 -= l.x * x4; x58 -= l.y * x5; x58 -= l.z * x6; x58 -= l.w * x7; } { const v4f l = GDN_L4(58, 2); x58 -= l.x * x8; x58 -= l.y * x9; x58 -= l.z * x10; x58 -= l.w * x11; } { const v4f l = GDN_L4(58, 3); x58 -= l.x * x12; x58 -= l.y * x13; x58 -= l.z * x14; x58 -= l.w * x15; } { const v4f l = GDN_L4(58, 4); x58 -= l.x * x16; x58 -= l.y * x17; x58 -= l.z * x18; x58 -= l.w * x19; } { const v4f l = GDN_L4(58, 5); x58 -= l.x * x20; x58 -= l.y * x21; x58 -= l.z * x22; x58 -= l.w * x23; } { const v4f l = GDN_L4(58, 6); x58 -= l.x * x24; x58 -= l.y * x25; x58 -= l.z * x26; x58 -= l.w * x27; } { const v4f l = GDN_L4(58, 7); x58 -= l.x * x28; x58 -= l.y * x29; x58 -= l.z * x30; x58 -= l.w * x31; } { const v4f l = GDN_L4(58, 8); x58 -= l.x * x32; x58 -= l.y * x33; x58 -= l.z * x34; x58 -= l.w * x35; } { const v4f l = GDN_L4(58, 9); x58 -= l.x * x36; x58 -= l.y * x37; x58 -= l.z * x38; x58 -= l.w * x39; } { const v4f l = GDN_L4(58, 10); x58 -= l.x * x40; x58 -= l.y * x41; x58 -= l.z * x42; x58 -= l.w * x43; } { const v4f l = GDN_L4(58, 11); x58 -= l.x * x44; x58 -= l.y * x45; x58 -= l.z * x46; x58 -= l.w * x47; } { const v4f l = GDN_L4(58, 12); x58 -= l.x * x48; x58 -= l.y * x49; x58 -= l.z * x50; x58 -= l.w * x51; } { const v4f l = GDN_L4(58, 13); x58 -= l.x * x52; x58 -= l.y * x53; x58 -= l.z * x54; x58 -= l.w * x55; } { const v4f l = GDN_L4(58, 14); x58 -= l.x * x56; x58 -= l.y * x57; } __builtin_amdgcn_sched_barrier(0);
        float x59 = GDN_RHS(59); { const v4f l = GDN_L4(59, 0); x59 -= l.x * x0; x59 -= l.y * x1; x59 -= l.z * x2; x59 -= l.w * x3; } { const v4f l = GDN_L4(59, 1); x59 -= l.x * x4; x59 -= l.y * x5; x59 -= l.z * x6; x59 -= l.w * x7; } { const v4f l = GDN_L4(59, 2); x59 -= l.x * x8; x59 -= l.y * x9; x59 -= l.z * x10; x59 -= l.w * x11; } { const v4f l = GDN_L4(59, 3); x59 -= l.x * x12; x59 -= l.y * x13; x59 -= l.z * x14; x59 -= l.w * x15; } { const v4f l = GDN_L4(59, 4); x59 -= l.x * x16; x59 -= l.y * x17; x59 -= l.z * x18; x59 -= l.w * x19; } { const v4f l = GDN_L4(59, 5); x59 -= l.x * x20; x59 -= l.y * x21; x59 -= l.z * x22; x59 -= l.w * x23; } { const v4f l = GDN_L4(59, 6); x59 -= l.x * x24; x59 -= l.y * x25; x59 -= l.z * x26; x59 -= l.w * x27; } { const v4f l = GDN_L4(59, 7); x59 -= l.x * x28; x59 -= l.y * x29; x59 -= l.z * x30; x59 -= l.w * x31; } { const v4f l = GDN_L4(59, 8); x59 -= l.x * x32; x59 -= l.y * x33; x59 -= l.z * x34; x59 -= l.w * x35; } { const v4f l = GDN_L4(59, 9); x59 -= l.x * x36; x59 -= l.y * x37; x59 -= l.z * x38; x59 -= l.w * x39; } { const v4f l = GDN_L4(59, 10); x59 -= l.x * x40; x59 -= l.y * x41; x59 -= l.z * x42; x59 -= l.w * x43; } { const v4f l = GDN_L4(59, 11); x59 -= l.x * x44; x59 -= l.y * x45; x59 -= l.z * x46; x59 -= l.w * x47; } { const v4f l = GDN_L4(59, 12); x59 -= l.x * x48; x59 -= l.y * x49; x59 -= l.z * x50; x59 -= l.w * x51; } { const v4f l = GDN_L4(59, 13); x59 -= l.x * x52; x59 -= l.y * x53; x59 -= l.z * x54; x59 -= l.w * x55; } { const v4f l = GDN_L4(59, 14); x59 -= l.x * x56; x59 -= l.y * x57; x59 -= l.z * x58; } __builtin_amdgcn_sched_barrier(0);
        float x60 = GDN_RHS(60); { const v4f l = GDN_L4(60, 0); x60 -= l.x * x0; x60 -= l.y * x1; x60 -= l.z * x2; x60 -= l.w * x3; } { const v4f l = GDN_L4(60, 1); x60 -= l.x * x4; x60 -= l.y * x5; x60 -= l.z * x6; x60 -= l.w * x7; } { const v4f l = GDN_L4(60, 2); x60 -= l.x * x8; x60 -= l.y * x9; x60 -= l.z * x10; x60 -= l.w * x11; } { const v4f l = GDN_L4(60, 3); x60 -= l.x * x12; x60 -= l.y * x13; x60 -= l.z * x14; x60 -= l.w * x15; } { const v4f l = GDN_L4(60, 4); x60 -= l.x * x16; x60 -= l.y * x17; x60 -= l.z * x18; x60 -= l.w * x19; } { const v4f l = GDN_L4(60, 5); x60 -= l.x * x20; x60 -= l.y * x21; x60 -= l.z * x22; x60 -= l.w * x23; } { const v4f l = GDN_L4(60, 6); x60 -= l.x * x24; x60 -= l.y * x25; x60 -= l.z * x26; x60 -= l.w * x27; } { const v4f l = GDN_L4(60, 7); x60 -= l.x * x28; x60 -= l.y * x29; x60 -= l.z * x30; x60 -= l.w * x31; } { const v4f l = GDN_L4(60, 8); x60 -= l.x * x32; x60 -= l.y * x33; x60 -= l.z * x34; x60 -= l.w * x35; } { const v4f l = GDN_L4(60, 9); x60 -= l.x * x36; x60 -= l.y * x37; x60 -= l.z * x38; x60 -= l.w * x39; } { const v4f l = GDN_L4(60, 10); x60 -= l.x * x40; x60 -= l.y * x41; x60 -= l.z * x42; x60 -= l.w * x43; } { const v4f l = GDN_L4(60, 11); x60 -= l.x * x44; x60 -= l.y * x45; x60 -= l.z * x46; x60 -= l.w * x47; } { const v4f l = GDN_L4(60, 12); x60 -= l.x * x48; x60 -= l.y * x49; x60 -= l.z * x50; x60 -= l.w * x51; } { const v4f l = GDN_L4(60, 13); x60 -= l.x * x52; x60 -= l.y * x53; x60 -= l.z * x54; x60 -= l.w * x55; } { const v4f l = GDN_L4(60, 14); x60 -= l.x * x56; x60 -= l.y * x57; x60 -= l.z * x58; x60 -= l.w * x59; } __builtin_amdgcn_sched_barrier(0);
        float x61 = GDN_RHS(61); { const v4f l = GDN_L4(61, 0); x61 -= l.x * x0; x61 -= l.y * x1; x61 -= l.z * x2; x61 -= l.w * x3; } { const v4f l = GDN_L4(61, 1); x61 -= l.x * x4; x61 -= l.y * x5; x61 -= l.z * x6; x61 -= l.w * x7; } { const v4f l = GDN_L4(61, 2); x61 -= l.x * x8; x61 -= l.y * x9; x61 -= l.z * x10; x61 -= l.w * x11; } { const v4f l = GDN_L4(61, 3); x61 -= l.x * x12; x61 -= l.y * x13; x61 -= l.z * x14; x61 -= l.w * x15; } { const v4f l = GDN_L4(61, 4); x61 -= l.x * x16; x61 -= l.y * x17; x61 -= l.z * x18; x61 -= l.w * x19; } { const v4f l = GDN_L4(61, 5); x61 -= l.x * x20; x61 -= l.y * x21; x61 -= l.z * x22; x61 -= l.w * x23; } { const v4f l = GDN_L4(61, 6); x61 -= l.x * x24; x61 -= l.y * x25; x61 -= l.z * x26; x61 -= l.w * x27; } { const v4f l = GDN_L4(61, 7); x61 -= l.x * x28; x61 -= l.y * x29; x61 -= l.z * x30; x61 -= l.w * x31; } { const v4f l = GDN_L4(61, 8); x61 -= l.x * x32; x61 -= l.y * x33; x61 -= l.z * x34; x61 -= l.w * x35; } { const v4f l = GDN_L4(61, 9); x61 -= l.x * x36; x61 -= l.y * x37; x61 -= l.z * x38; x61 -= l.w * x39; } { const v4f l = GDN_L4(61, 10); x61 -= l.x * x40; x61 -= l.y * x41; x61 -= l.z * x42; x61 -= l.w * x43; } { const v4f l = GDN_L4(61, 11); x61 -= l.x * x44; x61 -= l.y * x45; x61 -= l.z * x46; x61 -= l.w * x47; } { const v4f l = GDN_L4(61, 12); x61 -= l.x * x48; x61 -= l.y * x49; x61 -= l.z * x50; x61 -= l.w * x51; } { const v4f l = GDN_L4(61, 13); x61 -= l.x * x52; x61 -= l.y * x53; x61 -= l.z * x54; x61 -= l.w * x55; } { const v4f l = GDN_L4(61, 14); x61 -= l.x * x56; x61 -= l.y * x57; x61 -= l.z * x58; x61 -= l.w * x59; } { const v4f l = GDN_L4(61, 15); x61 -= l.x * x60; } __builtin_amdgcn_sched_barrier(0);
        float x62 = GDN_RHS(62); { const v4f l = GDN_L4(62, 0); x62 -= l.x * x0; x62 -= l.y * x1; x62 -= l.z * x2; x62 -= l.w * x3; } { const v4f l = GDN_L4(62, 1); x62 -= l.x * x4; x62 -= l.y * x5; x62 -= l.z * x6; x62 -= l.w * x7; } { const v4f l = GDN_L4(62, 2); x62 -= l.x * x8; x62 -= l.y * x9; x62 -= l.z * x10; x62 -= l.w * x11; } { const v4f l = GDN_L4(62, 3); x62 -= l.x * x12; x62 -= l.y * x13; x62 -= l.z * x14; x62 -= l.w * x15; } { const v4f l = GDN_L4(62, 4); x62 -= l.x * x16; x62 -= l.y * x17; x62 -= l.z * x18; x62 -= l.w * x19; } { const v4f l = GDN_L4(62, 5); x62 -= l.x * x20; x62 -= l.y * x21; x62 -= l.z * x22; x62 -= l.w * x23; } { const v4f l = GDN_L4(62, 6); x62 -= l.x * x24; x62 -= l.y * x25; x62 -= l.z * x26; x62 -= l.w * x27; } { const v4f l = GDN_L4(62, 7); x62 -= l.x * x28; x62 -= l.y * x29; x62 -= l.z * x30; x62 -= l.w * x31; } { const v4f l = GDN_L4(62, 8); x62 -= l.x * x32; x62 -= l.y * x33; x62 -= l.z * x34; x62 -= l.w * x35; } { const v4f l = GDN_L4(62, 9); x62 -= l.x * x36; x62 -= l.y * x37; x62 -= l.z * x38; x62 -= l.w * x39; } { const v4f l = GDN_L4(62, 10); x62 -= l.x * x40; x62 -= l.y * x41; x62 -= l.z * x42; x62 -= l.w * x43; } { const v4f l = GDN_L4(62, 11); x62 -= l.x * x44; x62 -= l.y * x45; x62 -= l.z * x46; x62 -= l.w * x47; } { const v4f l = GDN_L4(62, 12); x62 -= l.x * x48; x62 -= l.y * x49; x62 -= l.z * x50; x62 -= l.w * x51; } { const v4f l = GDN_L4(62, 13); x62 -= l.x * x52; x62 -= l.y * x53; x62 -= l.z * x54; x62 -= l.w * x55; } { const v4f l = GDN_L4(62, 14); x62 -= l.x * x56; x62 -= l.y * x57; x62 -= l.z * x58; x62 -= l.w * x59; } { const v4f l = GDN_L4(62, 15); x62 -= l.x * x60; x62 -= l.y * x61; } __builtin_amdgcn_sched_barrier(0);
        float x63 = GDN_RHS(63); { const v4f l = GDN_L4(63, 0); x63 -= l.x * x0; x63 -= l.y * x1; x63 -= l.z * x2; x63 -= l.w * x3; } { const v4f l = GDN_L4(63, 1); x63 -= l.x * x4; x63 -= l.y * x5; x63 -= l.z * x6; x63 -= l.w * x7; } { const v4f l = GDN_L4(63, 2); x63 -= l.x * x8; x63 -= l.y * x9; x63 -= l.z * x10; x63 -= l.w * x11; } { const v4f l = GDN_L4(63, 3); x63 -= l.x * x12; x63 -= l.y * x13; x63 -= l.z * x14; x63 -= l.w * x15; } { const v4f l = GDN_L4(63, 4); x63 -= l.x * x16; x63 -= l.y * x17; x63 -= l.z * x18; x63 -= l.w * x19; } { const v4f l = GDN_L4(63, 5); x63 -= l.x * x20; x63 -= l.y * x21; x63 -= l.z * x22; x63 -= l.w * x23; } { const v4f l = GDN_L4(63, 6); x63 -= l.x * x24; x63 -= l.y * x25; x63 -= l.z * x26; x63 -= l.w * x27; } { const v4f l = GDN_L4(63, 7); x63 -= l.x * x28; x63 -= l.y * x29; x63 -= l.z * x30; x63 -= l.w * x31; } { const v4f l = GDN_L4(63, 8); x63 -= l.x * x32; x63 -= l.y * x33; x63 -= l.z * x34; x63 -= l.w * x35; } { const v4f l = GDN_L4(63, 9); x63 -= l.x * x36; x63 -= l.y * x37; x63 -= l.z * x38; x63 -= l.w * x39; } { const v4f l = GDN_L4(63, 10); x63 -= l.x * x40; x63 -= l.y * x41; x63 -= l.z * x42; x63 -= l.w * x43; } { const v4f l = GDN_L4(63, 11); x63 -= l.x * x44; x63 -= l.y * x45; x63 -= l.z * x46; x63 -= l.w * x47; } { const v4f l = GDN_L4(63, 12); x63 -= l.x * x48; x63 -= l.y * x49; x63 -= l.z * x50; x63 -= l.w * x51; } { const v4f l = GDN_L4(63, 13); x63 -= l.x * x52; x63 -= l.y * x53; x63 -= l.z * x54; x63 -= l.w * x55; } { const v4f l = GDN_L4(63, 14); x63 -= l.x * x56; x63 -= l.y * x57; x63 -= l.z * x58; x63 -= l.w * x59; } { const v4f l = GDN_L4(63, 15); x63 -= l.x * x60; x63 -= l.y * x61; x63 -= l.z * x62; } __builtin_amdgcn_sched_barrier(0);
        if (c < 128) { GU[0 * 128 + c] = x0; GU[1 * 128 + c] = x1; GU[2 * 128 + c] = x2; GU[3 * 128 + c] = x3; GU[4 * 128 + c] = x4; GU[5 * 128 + c] = x5; GU[6 * 128 + c] = x6; GU[7 * 128 + c] = x7; GU[8 * 128 + c] = x8; GU[9 * 128 + c] = x9; GU[10 * 128 + c] = x10; GU[11 * 128 + c] = x11; GU[12 * 128 + c] = x12; GU[13 * 128 + c] = x13; GU[14 * 128 + c] = x14; GU[15 * 128 + c] = x15; GU[16 * 128 + c] = x16; GU[17 * 128 + c] = x17; GU[18 * 128 + c] = x18; GU[19 * 128 + c] = x19; GU[20 * 128 + c] = x20; GU[21 * 128 + c] = x21; GU[22 * 128 + c] = x22; GU[23 * 128 + c] = x23; GU[24 * 128 + c] = x24; GU[25 * 128 + c] = x25; GU[26 * 128 + c] = x26; GU[27 * 128 + c] = x27; GU[28 * 128 + c] = x28; GU[29 * 128 + c] = x29; GU[30 * 128 + c] = x30; GU[31 * 128 + c] = x31; GU[32 * 128 + c] = x32; GU[33 * 128 + c] = x33; GU[34 * 128 + c] = x34; GU[35 * 128 + c] = x35; GU[36 * 128 + c] = x36; GU[37 * 128 + c] = x37; GU[38 * 128 + c] = x38; GU[39 * 128 + c] = x39; GU[40 * 128 + c] = x40; GU[41 * 128 + c] = x41; GU[42 * 128 + c] = x42; GU[43 * 128 + c] = x43; GU[44 * 128 + c] = x44; GU[45 * 128 + c] = x45; GU[46 * 128 + c] = x46; GU[47 * 128 + c] = x47; GU[48 * 128 + c] = x48; GU[49 * 128 + c] = x49; GU[50 * 128 + c] = x50; GU[51 * 128 + c] = x51; GU[52 * 128 + c] = x52; GU[53 * 128 + c] = x53; GU[54 * 128 + c] = x54; GU[55 * 128 + c] = x55; GU[56 * 128 + c] = x56; GU[57 * 128 + c] = x57; GU[58 * 128 + c] = x58; GU[59 * 128 + c] = x59; GU[60 * 128 + c] = x60; GU[61 * 128 + c] = x61; GU[62 * 128 + c] = x62; GU[63 * 128 + c] = x63; }
        else { GNW[0 * 128 + (c - 128)] = (bf16)f2bf(-x0); GNW[1 * 128 + (c - 128)] = (bf16)f2bf(-x1); GNW[2 * 128 + (c - 128)] = (bf16)f2bf(-x2); GNW[3 * 128 + (c - 128)] = (bf16)f2bf(-x3); GNW[4 * 128 + (c - 128)] = (bf16)f2bf(-x4); GNW[5 * 128 + (c - 128)] = (bf16)f2bf(-x5); GNW[6 * 128 + (c - 128)] = (bf16)f2bf(-x6); GNW[7 * 128 + (c - 128)] = (bf16)f2bf(-x7); GNW[8 * 128 + (c - 128)] = (bf16)f2bf(-x8); GNW[9 * 128 + (c - 128)] = (bf16)f2bf(-x9); GNW[10 * 128 + (c - 128)] = (bf16)f2bf(-x10); GNW[11 * 128 + (c - 128)] = (bf16)f2bf(-x11); GNW[12 * 128 + (c - 128)] = (bf16)f2bf(-x12); GNW[13 * 128 + (c - 128)] = (bf16)f2bf(-x13); GNW[14 * 128 + (c - 128)] = (bf16)f2bf(-x14); GNW[15 * 128 + (c - 128)] = (bf16)f2bf(-x15); GNW[16 * 128 + (c - 128)] = (bf16)f2bf(-x16); GNW[17 * 128 + (c - 128)] = (bf16)f2bf(-x17); GNW[18 * 128 + (c - 128)] = (bf16)f2bf(-x18); GNW[19 * 128 + (c - 128)] = (bf16)f2bf(-x19); GNW[20 * 128 + (c - 128)] = (bf16)f2bf(-x20); GNW[21 * 128 + (c - 128)] = (bf16)f2bf(-x21); GNW[22 * 128 + (c - 128)] = (bf16)f2bf(-x22); GNW[23 * 128 + (c - 128)] = (bf16)f2bf(-x23); GNW[24 * 128 + (c - 128)] = (bf16)f2bf(-x24); GNW[25 * 128 + (c - 128)] = (bf16)f2bf(-x25); GNW[26 * 128 + (c - 128)] = (bf16)f2bf(-x26); GNW[27 * 128 + (c - 128)] = (bf16)f2bf(-x27); GNW[28 * 128 + (c - 128)] = (bf16)f2bf(-x28); GNW[29 * 128 + (c - 128)] = (bf16)f2bf(-x29); GNW[30 * 128 + (c - 128)] = (bf16)f2bf(-x30); GNW[31 * 128 + (c - 128)] = (bf16)f2bf(-x31); GNW[32 * 128 + (c - 128)] = (bf16)f2bf(-x32); GNW[33 * 128 + (c - 128)] = (bf16)f2bf(-x33); GNW[34 * 128 + (c - 128)] = (bf16)f2bf(-x34); GNW[35 * 128 + (c - 128)] = (bf16)f2bf(-x35); GNW[36 * 128 + (c - 128)] = (bf16)f2bf(-x36); GNW[37 * 128 + (c - 128)] = (bf16)f2bf(-x37); GNW[38 * 128 + (c - 128)] = (bf16)f2bf(-x38); GNW[39 * 128 + (c - 128)] = (bf16)f2bf(-x39); GNW[40 * 128 + (c - 128)] = (bf16)f2bf(-x40); GNW[41 * 128 + (c - 128)] = (bf16)f2bf(-x41); GNW[42 * 128 + (c - 128)] = (bf16)f2bf(-x42); GNW[43 * 128 + (c - 128)] = (bf16)f2bf(-x43); GNW[44 * 128 + (c - 128)] = (bf16)f2bf(-x44); GNW[45 * 128 + (c - 128)] = (bf16)f2bf(-x45); GNW[46 * 128 + (c - 128)] = (bf16)f2bf(-x46); GNW[47 * 128 + (c - 128)] = (bf16)f2bf(-x47); GNW[48 * 128 + (c - 128)] = (bf16)f2bf(-x48); GNW[49 * 128 + (c - 128)] = (bf16)f2bf(-x49); GNW[50 * 128 + (c - 128)] = (bf16)f2bf(-x50); GNW[51 * 128 + (c - 128)] = (bf16)f2bf(-x51); GNW[52 * 128 + (c - 128)] = (bf16)f2bf(-x52); GNW[53 * 128 + (c - 128)] = (bf16)f2bf(-x53); GNW[54 * 128 + (c - 128)] = (bf16)f2bf(-x54); GNW[55 * 128 + (c - 128)] = (bf16)f2bf(-x55); GNW[56 * 128 + (c - 128)] = (bf16)f2bf(-x56); GNW[57 * 128 + (c - 128)] = (bf16)f2bf(-x57); GNW[58 * 128 + (c - 128)] = (bf16)f2bf(-x58); GNW[59 * 128 + (c - 128)] = (bf16)f2bf(-x59); GNW[60 * 128 + (c - 128)] = (bf16)f2bf(-x60); GNW[61 * 128 + (c - 128)] = (bf16)f2bf(-x61); GNW[62 * 128 + (c - 128)] = (bf16)f2bf(-x62); GNW[63 * 128 + (c - 128)] = (bf16)f2bf(-x63); }
#undef GDN_RHS
#undef GDN_L4
    } else {
        const int t2 = tid - 256; const float gl = gcs[63];
        { const int i = t2 >> 2, d0 = (t2 & 3) * 32; const float e = __expf(gcs[i]);
#pragma unroll
          for (int x8 = 0; x8 < 4; ++x8) { const v4f a = *(const LAS v4f*)(qs + i * QP + d0 + 8 * x8), b = *(const LAS v4f*)(qs + i * QP + d0 + 8 * x8 + 4);
              v4u w; w.x = pk2(a.x * e, a.y * e); w.y = pk2(a.z * e, a.w * e); w.z = pk2(b.x * e, b.y * e); w.w = pk2(b.z * e, b.w * e); *(v4u*)(GQG + i * 128 + d0 + 8 * x8) = w; } }
        { const int d = t2 >> 1, j0 = (t2 & 1) * 32;
#pragma unroll
          for (int x8 = 0; x8 < 4; ++x8) { float o[8];
#pragma unroll
              for (int x = 0; x < 8; ++x) { const int j = j0 + 8 * x8 + x; o[x] = ks[j * QP + d] * __expf(gl - gcs[j]); }
              v4u w; w.x = pk2(o[0], o[1]); w.y = pk2(o[2], o[3]); w.z = pk2(o[4], o[5]); w.w = pk2(o[6], o[7]); *(v4u*)(GKT + d * 64 + j0 + 8 * x8) = w; } }
        if (t2 == 0) GDL[item] = __expf(gl);
    }
    __syncthreads();
}
struct GdnFrags { bf16x8_t nw[4], qg[4], at[2], kt[2][2]; float u[4]; float dl; };
__device__ __forceinline__ void gdn_load(GdnFrags& F, const Params& p, int item, int off128, int off64, int offk, int offu) {
    const bf16* GNW = (const bf16*)(p.ws + WS_GNW) + (size_t)item * 8192; const bf16* GQG = (const bf16*)(p.ws + WS_GQG) + (size_t)item * 8192;
    const bf16* GAT = (const bf16*)(p.ws + WS_GAT) + (size_t)item * 4096; const bf16* GKT = (const bf16*)(p.ws + WS_GKT) + (size_t)item * 8192; const float* GU = (const float*)(p.ws + WS_GU) + (size_t)item * 8192;
#pragma unroll
    for (int ks = 0; ks < 4; ++ks) { F.nw[ks] = *(const bf16x8_t*)(GNW + off128 + 32 * ks); F.qg[ks] = *(const bf16x8_t*)(GQG + off128 + 32 * ks); }
#pragma unroll
    for (int ks = 0; ks < 2; ++ks) { F.at[ks] = *(const bf16x8_t*)(GAT + off64 + 32 * ks); F.kt[0][ks] = *(const bf16x8_t*)(GKT + offk + 32 * ks); F.kt[1][ks] = *(const bf16x8_t*)(GKT + offk + 1024 + 32 * ks); }
#pragma unroll
    for (int r = 0; r < 4; ++r) F.u[r] = GU[offu + r * 128];
    F.dl = ((const float*)(p.ws + WS_GDL))[item];
}
constexpr int STP = 136, VNP = 72;
__device__ __forceinline__ void gdn_seq(const Params& p, LAS unsigned char* lds, int wgi, int wave, int lane) {
    const int u = wgi * 2 + (wave >> 2), wi = wave & 3, h = u >> 3, sl = u & 7, g = lane >> 4, c = lane & 15;
    LAS unsigned short* ST = (LAS unsigned short*)(lds + (wave >> 2) * 12288);
    LAS unsigned short* VNT = ST + 2 * 16 * STP;
    float* GO = (float*)(p.ws + WS_GO);
    const int off128 = (16 * wi + c) * 128 + 8 * g, off64 = (16 * wi + c) * 64 + 8 * g, offk = (32 * wi + c) * 64 + 8 * g, offu = (16 * wi + 4 * g) * 128 + 16 * sl + c;
#pragma unroll
    for (int mt = 0; mt < 2; ++mt) *(LAS v2u*)(ST + c * STP + 16 * (2 * wi + mt) + 4 * g) = (v2u){0u, 0u};
    pg8::f32x4 Sacc[2] = {{0.f, 0.f, 0.f, 0.f}, {0.f, 0.f, 0.f, 0.f}};
    __syncthreads();
    GdnFrags F0, F1;
    gdn_load(F0, p, h, off128, off64, offk, offu);
#define GDN_STEP(F, n_) do { const int cur = (n_) & 1; bf16x8_t sf[4]; \
        _Pragma("unroll") for (int ks = 0; ks < 4; ++ks) sf[ks] = *(const LAS bf16x8_t*)(ST + cur * 16 * STP + c * STP + 32 * ks + 8 * g); \
        pg8::f32x4 vn = {F.u[0], F.u[1], F.u[2], F.u[3]}; \
        _Pragma("unroll") for (int ks = 0; ks < 4; ++ks) vn = __builtin_amdgcn_mfma_f32_16x16x32_bf16(F.nw[ks], sf[ks], vn, 0, 0, 0); \
        { v2u w; w.x = pk2(vn[0], vn[1]); w.y = pk2(vn[2], vn[3]); *(LAS v2u*)(VNT + c * VNP + 16 * wi + 4 * g) = w; } \
        LDS_BAR(); \
        const bf16x8_t v0 = *(const LAS bf16x8_t*)(VNT + c * VNP + 8 * g), v1 = *(const LAS bf16x8_t*)(VNT + c * VNP + 32 + 8 * g); \
        pg8::f32x4 o = {0.f, 0.f, 0.f, 0.f}; \
        _Pragma("unroll") for (int ks = 0; ks < 4; ++ks) o = __builtin_amdgcn_mfma_f32_16x16x32_bf16(F.qg[ks], sf[ks], o, 0, 0, 0); \
        o = __builtin_amdgcn_mfma_f32_16x16x32_bf16(F.at[0], v0, o, 0, 0, 0); o = __builtin_amdgcn_mfma_f32_16x16x32_bf16(F.at[1], v1, o, 0, 0, 0); \
        { const size_t tb = (size_t)(n_) * 64 + 16 * wi + 4 * g; _Pragma("unroll") for (int r = 0; r < 4; ++r) GO[(tb + r) * BW + h * 128 + 16 * sl + c] = o[r]; } \
        _Pragma("unroll") for (int mt = 0; mt < 2; ++mt) { Sacc[mt] = Sacc[mt] * F.dl; \
            Sacc[mt] = __builtin_amdgcn_mfma_f32_16x16x32_bf16(F.kt[mt][0], v0, Sacc[mt], 0, 0, 0); Sacc[mt] = __builtin_amdgcn_mfma_f32_16x16x32_bf16(F.kt[mt][1], v1, Sacc[mt], 0, 0, 0); \
            v2u w; w.x = pk2(Sacc[mt][0], Sacc[mt][1]); w.y = pk2(Sacc[mt][2], Sacc[mt][3]); *(LAS v2u*)(ST + (cur ^ 1) * 16 * STP + c * STP + 16 * (2 * wi + mt) + 4 * g) = w; } \
        LDS_BAR(); } while (0)
    for (int n = 0; n < T / 64; n += 2) {
        gdn_load(F1, p, (n + 1) * 4 + h, off128, off64, offk, offu);
        GDN_STEP(F0, n);
        gdn_load(F0, p, ((n + 2 < T / 64) ? n + 2 : n) * 4 + h, off128, off64, offk, offu);
        GDN_STEP(F1, n + 1);
    }
#undef GDN_STEP
}

constexpr int SEQ_UOFF = 132096;
constexpr int GI_NW = 0, GI_QG = 8704, GI_AT = 17408, GI_KT = 22016, GI_SZ = 31232;
struct GdnStage { v4u r[7]; float u[4]; float dl; };
__device__ __forceinline__ void gdn_stage_load(GdnStage& Sg, const Params& p, int item, int tid, int offu) {
    const bf16* GNW = (const bf16*)(p.ws + WS_GNW) + (size_t)item * 8192; const bf16* GQG = (const bf16*)(p.ws + WS_GQG) + (size_t)item * 8192;
    const bf16* GAT = (const bf16*)(p.ws + WS_GAT) + (size_t)item * 4096; const bf16* GKT = (const bf16*)(p.ws + WS_GKT) + (size_t)item * 8192; const float* GU = (const float*)(p.ws + WS_GU) + (size_t)item * 8192;
    Sg.r[0] = *(const v4u*)(GNW + 8 * tid); Sg.r[1] = *(const v4u*)(GNW + 8 * (tid + 512)); Sg.r[2] = *(const v4u*)(GQG + 8 * tid); Sg.r[3] = *(const v4u*)(GQG + 8 * (tid + 512));
    Sg.r[4] = *(const v4u*)(GAT + 8 * tid); Sg.r[5] = *(const v4u*)(GKT + 8 * tid); Sg.r[6] = *(const v4u*)(GKT + 8 * (tid + 512));
#pragma unroll
    for (int r = 0; r < 4; ++r) Sg.u[r] = GU[offu + r * 128];
    Sg.dl = ((const float*)(p.ws + WS_GDL))[item];
}
__device__ __forceinline__ void gdn_stage_write(const GdnStage& Sg, LAS unsigned short* img, int tid) {
    { const int p0 = tid, p1 = tid + 512;
      *(LAS v4u*)(img + GI_NW + (p0 >> 4) * 136 + 8 * (p0 & 15)) = Sg.r[0]; *(LAS v4u*)(img + GI_NW + (p1 >> 4) * 136 + 8 * (p1 & 15)) = Sg.r[1];
      *(LAS v4u*)(img + GI_QG + (p0 >> 4) * 136 + 8 * (p0 & 15)) = Sg.r[2]; *(LAS v4u*)(img + GI_QG + (p1 >> 4) * 136 + 8 * (p1 & 15)) = Sg.r[3];
      *(LAS v4u*)(img + GI_AT + (p0 >> 3) * 72 + 8 * (p0 & 7)) = Sg.r[4];
      *(LAS v4u*)(img + GI_KT + (p0 >> 3) * 72 + 8 * (p0 & 7)) = Sg.r[5]; *(LAS v4u*)(img + GI_KT + (p1 >> 3) * 72 + 8 * (p1 & 7)) = Sg.r[6]; }
}
__device__ __forceinline__ void gdn_seq2(const Params& p, LAS unsigned char* lds, int wgi, int tid, int wave, int lane) {
    const int h = wgi >> 2, sl = 2 * (wgi & 3) + (wave >> 2), wi = wave & 3, g = lane >> 4, c = lane & 15;
    LAS unsigned short* IMG = (LAS unsigned short*)lds;
    LAS unsigned short* ST = (LAS unsigned short*)(lds + SEQ_UOFF + (wave >> 2) * 12288);
    LAS unsigned short* VNT = ST + 2 * 16 * STP;
    float* GO = (float*)(p.ws + WS_GO);
    const int offu = (16 * wi + 4 * g) * 128 + 16 * sl + c;
#pragma unroll
    for (int mt = 0; mt < 2; ++mt) *(LAS v2u*)(ST + c * STP + 16 * (2 * wi + mt) + 4 * g) = (v2u){0u, 0u};
    pg8::f32x4 Sacc[2] = {{0.f, 0.f, 0.f, 0.f}, {0.f, 0.f, 0.f, 0.f}};
    GdnStage A, B;
    gdn_stage_load(A, p, h, tid, offu); gdn_stage_write(A, IMG, tid);
    gdn_stage_load(B, p, 4 + h, tid, offu);
    LDS_BAR();
    constexpr int NCH = T / 64;
#define GDN_STEP2(X, Y, n_) do { const int cur = (n_) & 1; const LAS unsigned short* im = IMG + cur * GI_SZ; bf16x8_t sf[4]; \
        _Pragma("unroll") for (int ks = 0; ks < 4; ++ks) sf[ks] = *(const LAS bf16x8_t*)(ST + cur * 16 * STP + c * STP + 32 * ks + 8 * g); \
        pg8::f32x4 vn = {X.u[0], X.u[1], X.u[2], X.u[3]}; const float dl = X.dl; \
        _Pragma("unroll") for (int ks = 0; ks < 4; ++ks) vn = __builtin_amdgcn_mfma_f32_16x16x32_bf16(*(const LAS bf16x8_t*)(im + GI_NW + (16 * wi + c) * 136 + 32 * ks + 8 * g), sf[ks], vn, 0, 0, 0); \
        { v2u w; w.x = pk2(vn[0], vn[1]); w.y = pk2(vn[2], vn[3]); *(LAS v2u*)(VNT + c * VNP + 16 * wi + 4 * g) = w; } \
        pg8::f32x4 o = {0.f, 0.f, 0.f, 0.f}; \
        _Pragma("unroll") for (int ks = 0; ks < 4; ++ks) o = __builtin_amdgcn_mfma_f32_16x16x32_bf16(*(const LAS bf16x8_t*)(im + GI_QG + (16 * wi + c) * 136 + 32 * ks + 8 * g), sf[ks], o, 0, 0, 0); \
        LDS_BAR(); \
        gdn_stage_load(X, p, (((n_) + 2 < NCH) ? (n_) + 2 : (n_)) * 4 + h, tid, offu); \
        const bf16x8_t v0 = *(const LAS bf16x8_t*)(VNT + c * VNP + 8 * g), v1 = *(const LAS bf16x8_t*)(VNT + c * VNP + 32 + 8 * g); \
        o = __builtin_amdgcn_mfma_f32_16x16x32_bf16(*(const LAS bf16x8_t*)(im + GI_AT + (16 * wi + c) * 72 + 8 * g), v0, o, 0, 0, 0); \
        o = __builtin_amdgcn_mfma_f32_16x16x32_bf16(*(const LAS bf16x8_t*)(im + GI_AT + (16 * wi + c) * 72 + 32 + 8 * g), v1, o, 0, 0, 0); \
        { const size_t tb = (size_t)(n_) * 64 + 16 * wi + 4 * g; _Pragma("unroll") for (int r = 0; r < 4; ++r) GO[(tb + r) * BW + h * 128 + 16 * sl + c] = o[r]; } \
        _Pragma("unroll") for (int mt = 0; mt < 2; ++mt) { Sacc[mt] = Sacc[mt] * dl; \
            Sacc[mt] = __builtin_amdgcn_mfma_f32_16x16x32_bf16(*(const LAS bf16x8_t*)(im + GI_KT + (16 * (2 * wi + mt) + c) * 72 + 8 * g), v0, Sacc[mt], 0, 0, 0); \
            Sacc[mt] = __builtin_amdgcn_mfma_f32_16x16x32_bf16(*(const LAS bf16x8_t*)(im + GI_KT + (16 * (2 * wi + mt) + c) * 72 + 32 + 8 * g), v1, Sacc[mt], 0, 0, 0); \
            v2u w; w.x = pk2(Sacc[mt][0], Sacc[mt][1]); w.y = pk2(Sacc[mt][2], Sacc[mt][3]); *(LAS v2u*)(ST + (cur ^ 1) * 16 * STP + c * STP + 16 * (2 * wi + mt) + 4 * g) = w; } \
        gdn_stage_write(Y, IMG + (cur ^ 1) * GI_SZ, tid); \
        LDS_BAR(); } while (0)
    for (int n = 0; n < NCH; n += 2) { GDN_STEP2(A, B, n); GDN_STEP2(B, A, n + 1); }
#undef GDN_STEP2
}
constexpr int MI_Q = 0, MI_S = 4608, MI_K = 9216, MI_SZ = 13824;
struct MlStage { v4u r[3]; bf16x8_t vt[2]; float fl; };
__device__ __forceinline__ void ml_stage_load(MlStage& Sg, const Params& p, int item, int tid, int offV) {
    const bf16* MQ = (const bf16*)(p.ws + WS_MQ) + (size_t)item * 4096; const bf16* MS = (const bf16*)(p.ws + WS_MS) + (size_t)item * 4096; const bf16* MK = (const bf16*)(p.ws + WS_MK) + (size_t)item * 4096;
    const bf16* MV = (const bf16*)(p.ws + WS_MV) + (size_t)item * 9216;
    Sg.r[0] = *(const v4u*)(MQ + 8 * tid); Sg.r[1] = *(const v4u*)(MS + 8 * tid); Sg.r[2] = *(const v4u*)(MK + 8 * tid);
    Sg.vt[0] = *(const bf16x8_t*)(MV + offV); Sg.vt[1] = *(const bf16x8_t*)(MV + offV + 32);
    Sg.fl = ((const float*)(p.ws + WS_MFL))[item];
}
__device__ __forceinline__ void ml_stage_write(const MlStage& Sg, LAS unsigned short* img, int tid) {
    const int o = (tid >> 3) * 72 + 8 * (tid & 7);
    *(LAS v4u*)(img + MI_Q + o) = Sg.r[0]; *(LAS v4u*)(img + MI_S + o) = Sg.r[1]; *(LAS v4u*)(img + MI_K + o) = Sg.r[2];
}
__device__ __forceinline__ void ml_seq2(const Params& p, LAS unsigned char* lds, int wgi, int tid, int wave, int lane) {
    const int h = wgi / 5, sl0 = 2 * (wgi % 5) + (wave >> 2), wi = wave & 3, g = lane >> 4, c = lane & 15;
    const bool real = sl0 < 9; const int sl = real ? sl0 : 8;
    LAS unsigned short* IMG = (LAS unsigned short*)lds;
    LAS unsigned short* CT = (LAS unsigned short*)(lds + SEQ_UOFF + (wave >> 2) * 8192);
    float* HO = (float*)(p.ws + WS_HO); float* HDEN = (float*)(p.ws + WS_HDEN);
    const int offV = (16 * sl + c) * 64 + 8 * g;
    *(LAS v2u*)(CT + c * 72 + 16 * wi + 4 * g) = (v2u){0u, 0u};
    pg8::f32x4 Cacc = {0.f, 0.f, 0.f, 0.f};
    MlStage A, B;
    ml_stage_load(A, p, h, tid, offV); ml_stage_write(A, IMG, tid);
    ml_stage_load(B, p, 4 + h, tid, offV);
    LDS_BAR();
    constexpr int NCH = T / 64;
#define ML_STEP2(X, Y, n_) do { const int cur = (n_) & 1; const LAS unsigned short* im = IMG + cur * MI_SZ; const int ro = (16 * wi + c) * 72 + 8 * g; \
        const bf16x8_t c0 = *(const LAS bf16x8_t*)(CT + cur * 16 * 72 + c * 72 + 8 * g), c1 = *(const LAS bf16x8_t*)(CT + cur * 16 * 72 + c * 72 + 32 + 8 * g); \
        const bf16x8_t vt0 = X.vt[0], vt1 = X.vt[1]; const float fl = X.fl; \
        pg8::f32x4 num = {0.f, 0.f, 0.f, 0.f}; \
        num = __builtin_amdgcn_mfma_f32_16x16x32_bf16(*(const LAS bf16x8_t*)(im + MI_Q + ro), c0, num, 0, 0, 0); num = __builtin_amdgcn_mfma_f32_16x16x32_bf16(*(const LAS bf16x8_t*)(im + MI_Q + ro + 32), c1, num, 0, 0, 0); \
        num = __builtin_amdgcn_mfma_f32_16x16x32_bf16(*(const LAS bf16x8_t*)(im + MI_S + ro), vt0, num, 0, 0, 0); num = __builtin_amdgcn_mfma_f32_16x16x32_bf16(*(const LAS bf16x8_t*)(im + MI_S + ro + 32), vt1, num, 0, 0, 0); \
        Cacc = Cacc * fl; \
        Cacc = __builtin_amdgcn_mfma_f32_16x16x32_bf16(*(const LAS bf16x8_t*)(im + MI_K + ro), vt0, Cacc, 0, 0, 0); Cacc = __builtin_amdgcn_mfma_f32_16x16x32_bf16(*(const LAS bf16x8_t*)(im + MI_K + ro + 32), vt1, Cacc, 0, 0, 0); \
        ml_stage_load(X, p, (((n_) + 2 < NCH) ? (n_) + 2 : (n_)) * 4 + h, tid, offV); \
        { v2u w; w.x = pk2(Cacc[0], Cacc[1]); w.y = pk2(Cacc[2], Cacc[3]); *(LAS v2u*)(CT + (cur ^ 1) * 16 * 72 + c * 72 + 16 * wi + 4 * g) = w; } \
        { const size_t tb = (size_t)(n_) * 64 + 16 * wi + 4 * g; \
          if (sl < 8) { _Pragma("unroll") for (int r = 0; r < 4; ++r) HO[(tb + r) * BW + h * 128 + 16 * sl + c] = num[r]; } \
          else if (c == 0 && real) { _Pragma("unroll") for (int r = 0; r < 4; ++r) HDEN[(tb + r) * 4 + h] = num[r]; } } \
        ml_stage_write(Y, IMG + (cur ^ 1) * MI_SZ, tid); \
        LDS_BAR(); } while (0)
    for (int n = 0; n < NCH; n += 2) { ML_STEP2(A, B, n); ML_STEP2(B, A, n + 1); }
#undef ML_STEP2
}

__device__ __forceinline__ void mixer_gmlp_item(const Params& p, int l, LAS unsigned char* lds, int item, int tid, int wave, int lane) {
    const int chunk = item >> 2, g = item & 3; const size_t tok0 = (size_t)chunk * 128;
    const bf16* Z = (const bf16*)(p.ws + WS_Z); bf16* BR1 = (bf16*)(p.ws + WS_BR) + (size_t)1 * T * BW;
    const float* ng = p.in[I_GMNG] + l * BW; const float* nb = p.in[I_GMNB] + l * BW;
    const float* wsp = p.in[I_GMWS] + ((size_t)(l * 4 + g) * 128) * 128; const float* bsp = p.in[I_GMBS] + (l * 4 + g) * 128;
    LAS float* vn = (LAS float*)lds;
    for (int r = 0; r < 16; ++r) { const int tk = wave * 16 + r;
        const v4u raw = *(const v4u*)(Z + (tok0 + tk) * ZC + ZC_GMV + 8 * lane); float x[8]; unpack8(raw, x); float s = 0.f;
#pragma unroll
        for (int i = 0; i < 8; ++i) { x[i] = gelu_tanh(x[i]); s += x[i]; }
        const float mean = wave_sum(s) * (1.f / 512.f); float ss = 0.f;
#pragma unroll
        for (int i = 0; i < 8; ++i) { x[i] -= mean; ss += x[i] * x[i]; }
        const float rstd = rsqrtf(wave_sum(ss) * (1.f / 512.f) + LN_EPS);
        if ((lane >> 4) == g) { const int cl = 8 * (lane & 15);
#pragma unroll
            for (int i = 0; i < 8; ++i) vn[tk * 128 + cl + i] = x[i] * rstd * ng[8 * lane + i] + nb[8 * lane + i]; }
    }
    __syncthreads();
    const int t = tid >> 2, cq = tid & 3; float acc[32];
#pragma unroll
    for (int i = 0; i < 32; ++i) acc[i] = 0.f;
    const float* wrow = wsp + (size_t)t * 128;
    for (int s = 0; s <= t; ++s) { const float w = wrow[s]; const LAS float* row = vn + s * 128 + cq * 32;
#pragma unroll
        for (int i4 = 0; i4 < 8; ++i4) { const v4f a = *(const LAS v4f*)(row + 4 * i4); acc[4 * i4] += w * a.x; acc[4 * i4 + 1] += w * a.y; acc[4 * i4 + 2] += w * a.z; acc[4 * i4 + 3] += w * a.w; } }
    const float bias = bsp[t];
#pragma unroll
    for (int i8 = 0; i8 < 4; ++i8) { const v4u raw = *(const v4u*)(Z + (tok0 + t) * ZC + ZC_GMU + g * 128 + cq * 32 + 8 * i8); float u[8]; unpack8(raw, u); float o[8];
#pragma unroll
        for (int i = 0; i < 8; ++i) o[i] = gelu_tanh(u[i]) * (acc[8 * i8 + i] + bias);
        v4u w; w.x = pk2(o[0], o[1]); w.y = pk2(o[2], o[3]); w.z = pk2(o[4], o[5]); w.w = pk2(o[6], o[7]);
        *(v4u*)(BR1 + (tok0 + t) * BW + g * 128 + cq * 32 + 8 * i8) = w; }
    __syncthreads();
}

__device__ __forceinline__ void vt_item(const Params& p, LAS unsigned char* lds, int item, int tid) {
    const int h = item & 3, n = item >> 2; const size_t t0 = (size_t)n * 64;
    const bf16* Z = (const bf16*)(p.ws + WS_Z); bf16* VT = (bf16*)(p.ws + WS_VT);
    LAS unsigned short* vs = (LAS unsigned short*)lds;
#pragma unroll
    for (int r = 0; r < 2; ++r) { const int idx = tid + 512 * r, tk = idx >> 4, c8 = idx & 15;
        *(LAS v4u*)(vs + tk * 136 + 8 * c8) = *(const v4u*)(Z + (t0 + tk) * ZC + ZC_SBV + h * 128 + 8 * c8); }
    __syncthreads();
    { const int d = tid >> 2, jq = tid & 3; unsigned w[8];
#pragma unroll
      for (int x = 0; x < 8; ++x) w[x] = (unsigned)vs[(16 * jq + 2 * x) * 136 + d] | ((unsigned)vs[(16 * jq + 2 * x + 1) * 136 + d] << 16);
      bf16* dst = VT + ((size_t)h * 128 + d) * T + t0 + 16 * jq;
      *(v4u*)dst = (v4u){w[0], w[1], w[2], w[3]}; *(v4u*)(dst + 8) = (v4u){w[4], w[5], w[6], w[7]}; }
    __syncthreads();
}
constexpr int KTP = 136, VTP = 72;
__device__ __forceinline__ void sb_unit(const Params& p, LAS unsigned char* lds, int unit, int tid, int wave, int lane) {
    const int h = unit >> 6, q0 = (unit & 63) * 128, g = lane >> 4, c = lane & 15; const int qrow = q0 + 16 * wave + c;
    const bf16* Z = (const bf16*)(p.ws + WS_Z); const bf16* VT = (const bf16*)(p.ws + WS_VT) + (size_t)h * 128 * T; bf16* BR0 = (bf16*)(p.ws + WS_BR);
    LAS unsigned short* Kt = (LAS unsigned short*)lds;
    LAS unsigned short* Vt = Kt + 2 * 64 * KTP;
    LAS int* flags = (LAS int*)(Vt + 2 * 128 * VTP);
    bf16x8_t qf[4];
#pragma unroll
    for (int ks = 0; ks < 4; ++ks) qf[ks] = *(const bf16x8_t*)(Z + (size_t)qrow * ZC + ZC_SBQ + h * 128 + 32 * ks + 8 * g);
    pg8::f32x4 acc[8];
#pragma unroll
    for (int dt = 0; dt < 8; ++dt) acc[dt] = (pg8::f32x4){0.f, 0.f, 0.f, 0.f};
    float racc = 0.f;
    v4u kr[2], vr[2];
    const int jt = (q0 >> 6) + 1;
#define SB_GLOAD(j_) do { _Pragma("unroll") for (int r = 0; r < 2; ++r) { const int idx = tid + 512 * r; \
        kr[r] = *(const v4u*)(Z + (size_t)(64 * (j_) + (idx >> 4)) * ZC + ZC_SBK + h * 128 + 8 * (idx & 15)); \
        vr[r] = *(const v4u*)(VT + (size_t)(idx >> 3) * T + 64 * (j_) + 8 * (idx & 7)); } } while (0)
#define SB_LWRITE(b_) do { _Pragma("unroll") for (int r = 0; r < 2; ++r) { const int idx = tid + 512 * r; \
        *(LAS v4u*)(Kt + (b_) * 64 * KTP + (idx >> 4) * KTP + 8 * (idx & 15)) = kr[r]; *(LAS v4u*)(Vt + (b_) * 128 * VTP + (idx >> 3) * VTP + 8 * (idx & 7)) = vr[r]; } } while (0)
    LDS_BAR();
    SB_GLOAD(jt); SB_LWRITE(0);
    LDS_BAR();
    for (int j = jt, it = 0; j >= 0; --j, ++it) {
        const int cur = it & 1;
        SB_GLOAD(j > 0 ? j - 1 : 0);
        const bool wdone = __all(racc > 104.f);
        if (64 * j < q0 + 16 * wave + 15 && !wdone) {
            const LAS unsigned short* Kc = Kt + cur * 64 * KTP; const LAS unsigned short* Vc = Vt + cur * 128 * VTP;
            pg8::f32x4 z[4];
#pragma unroll
            for (int s = 0; s < 4; ++s) { z[s] = (pg8::f32x4){0.f, 0.f, 0.f, 0.f};
#pragma unroll
                for (int ks = 0; ks < 4; ++ks) z[s] = __builtin_amdgcn_mfma_f32_16x16x32_bf16(*(const LAS bf16x8_t*)(Kc + (16 * s + c) * KTP + 32 * ks + 8 * g), qf[ks], z[s], 0, 0, 0); }
            float sp[4][4], t[4], xs[4]; bool mk[4][4];
#pragma unroll
            for (int s = 0; s < 4; ++s) { t[s] = 0.f;
#pragma unroll
                for (int r = 0; r < 4; ++r) { const int key = 64 * j + 16 * s + 4 * g + r; mk[s][r] = key < qrow; const float zz = z[s][r] * 0.08838834764831845f; z[s][r] = zz;
                    sp[s][r] = mk[s][r] ? softplusf_(zz) : 0.f; t[s] += sp[s][r]; } }
            float grand = 0.f, higher[4];
#pragma unroll
            for (int s = 3; s >= 0; --s) { float x = t[s]; float y = __shfl(x, lane + 16); x += (g < 3) ? y : 0.f; y = __shfl(x, lane + 32); x += (g < 2) ? y : 0.f;
                xs[s] = x - t[s];
                const float tot = __shfl(x, c); higher[s] = grand; grand += tot; }
            bf16x8_t pf[2];
#pragma unroll
            for (int s = 0; s < 4; ++s) { float a[4]; float e = 0.f;
#pragma unroll
                for (int r = 3; r >= 0; --r) { const float la = z[s][r] - sp[s][r] - (racc + higher[s] + xs[s] + e); a[r] = mk[s][r] ? __expf(la) : 0.f; e += sp[s][r]; }
                const unsigned w0 = pk2(a[0], a[1]), w1 = pk2(a[2], a[3]);
                if ((s & 1) == 0) { pf[s >> 1][0] = (short)(w0 & 0xffff); pf[s >> 1][1] = (short)(w0 >> 16); pf[s >> 1][2] = (short)(w1 & 0xffff); pf[s >> 1][3] = (short)(w1 >> 16); }
                else              { pf[s >> 1][4] = (short)(w0 & 0xffff); pf[s >> 1][5] = (short)(w0 >> 16); pf[s >> 1][6] = (short)(w1 & 0xffff); pf[s >> 1][7] = (short)(w1 >> 16); } }
            racc += grand;
#pragma unroll
            for (int dt = 0; dt < 8; ++dt)
#pragma unroll
                for (int k2 = 0; k2 < 2; ++k2) { const v2u lo = *(const LAS v2u*)(Vc + (16 * dt + c) * VTP + 32 * k2 + 4 * g), hi = *(const LAS v2u*)(Vc + (16 * dt + c) * VTP + 32 * k2 + 16 + 4 * g);
                    const v4u vv = (v4u){lo.x, lo.y, hi.x, hi.y};
                    acc[dt] = __builtin_amdgcn_mfma_f32_16x16x32_bf16(__builtin_bit_cast(bf16x8_t, vv), pf[k2], acc[dt], 0, 0, 0); }
        }
        const bool wd2 = __all(racc > 104.f);
        if (lane == 0) flags[cur * 8 + wave] = wd2 ? 1 : 0;
        SB_LWRITE(cur ^ 1);
        LDS_BAR();
        int alld = 1;
#pragma unroll
        for (int w = 0; w < 8; ++w) alld &= flags[cur * 8 + w];
        if (alld) break;
    }
#undef SB_GLOAD
#undef SB_LWRITE
#pragma unroll
    for (int dt = 0; dt < 8; ++dt) { v2u w; w.x = pk2(acc[dt][0], acc[dt][1]); w.y = pk2(acc[dt][2], acc[dt][3]); *(v2u*)(BR0 + (size_t)qrow * BW + h * 128 + 16 * dt + 4 * g) = w; }
}

__device__ __forceinline__ void phase_mixers(const Params& p, int l, LAS unsigned char* lds, int wg, int G, int tid, int wave, int lane, const XcdBarrier& bar) {
#if defined(PROBE_SPLIT)
    if (wg < 16) gdn_seq2(p, lds, wg, tid, wave, lane); else if (wg < 36) ml_seq2(p, lds, wg - 16, tid, wave, lane);
    xcd_barrier(bar);
    const int w2 = wg, G2 = G;
#else
    if (wg < 16) { gdn_seq2(p, lds, wg, tid, wave, lane); return; }
    if (wg < 36) { ml_seq2(p, lds, wg - 16, tid, wave, lane); return; }
    const int w2 = wg - 36, G2 = G - 36;
#endif
    for (int it = w2; it < 256; it += G2) mixer_gmlp_item(p, l, lds, it, tid, wave, lane);
    for (int it = w2; it < 256; it += G2) sb_unit(p, lds, it, tid, wave, lane);
#if !defined(PROBE_CONV0)
    __syncthreads();
    phase_convert<1>(p, l, lds, w2 * 8 + wave, G2 * 8, wave, lane);
#endif
}

__device__ __forceinline__ void phase_post(const Params& p, int l, int gw, int NGW, int lane) {
    const bf16* Z = (const bf16*)(p.ws + WS_Z); const float* GO = (const float*)(p.ws + WS_GO); const float* HO = (const float*)(p.ws + WS_HO); const float* HDEN = (const float*)(p.ws + WS_HDEN);
    bf16* BR2 = (bf16*)(p.ws + WS_BR) + (size_t)2 * T * BW; bf16* BR3 = (bf16*)(p.ws + WS_BR) + (size_t)3 * T * BW;
    const float* gng = p.in[I_GDNNG] + l * 128; const float* mng = p.in[I_MLNG] + l * BW;
    for (int t = gw; t < T; t += NGW) {
        {   const v4f a0 = *(const v4f*)(GO + (size_t)t * BW + 8 * lane), a1 = *(const v4f*)(GO + (size_t)t * BW + 8 * lane + 4); float o[8] = {a0.x, a0.y, a0.z, a0.w, a1.x, a1.y, a1.z, a1.w}; float ss = 0.f;
#pragma unroll
            for (int i = 0; i < 8; ++i) ss += o[i] * o[i];
            const float r = rsqrtf(sum16(ss) * (1.f / 128.f) + LN_EPS);
            const v4u graw = *(const v4u*)(Z + (size_t)t * ZC + ZC_GDNG + 8 * lane); float gt[8]; unpack8(graw, gt);
#pragma unroll
            for (int i = 0; i < 8; ++i) o[i] = o[i] * r * gng[(8 * lane + i) & 127] * siluf_(gt[i]);
            v4u w; w.x = pk2(o[0], o[1]); w.y = pk2(o[2], o[3]); w.z = pk2(o[4], o[5]); w.w = pk2(o[6], o[7]); *(v4u*)(BR2 + (size_t)t * BW + 8 * lane) = w; }
        {   const v4f a0 = *(const v4f*)(HO + (size_t)t * BW + 8 * lane), a1 = *(const v4f*)(HO + (size_t)t * BW + 8 * lane + 4); float o[8] = {a0.x, a0.y, a0.z, a0.w, a1.x, a1.y, a1.z, a1.w}; float ss = 0.f;
            const float dn = 1.f / fmaxf(fabsf(HDEN[(size_t)t * 4 + (lane >> 4)]), 1.f);
#pragma unroll
            for (int i = 0; i < 8; ++i) { o[i] *= dn; ss += o[i] * o[i]; }
            const float r = rsqrtf(sum16(ss) * (1.f / 128.f) + LN_EPS);
            const v4u graw = *(const v4u*)(Z + (size_t)t * ZC + ZC_MLO + 8 * lane); float gt[8]; unpack8(graw, gt);
#pragma unroll
            for (int i = 0; i < 8; ++i) o[i] = o[i] * r * mng[8 * lane + i] * sigmoidf_(gt[i]);
            v4u w; w.x = pk2(o[0], o[1]); w.y = pk2(o[2], o[3]); w.z = pk2(o[4], o[5]); w.w = pk2(o[6], o[7]); *(v4u*)(BR3 + (size_t)t * BW + 8 * lane) = w; }
    }
}

__device__ __forceinline__ void ln_row(const float* yrow, const float* g, const float* b, int lane, v4f (&v)[8]) {
    const v4f* yr = (const v4f*)yrow + lane; float s = 0.f;
#pragma unroll
    for (int j = 0; j < 8; ++j) { v[j] = yr[64 * j]; s += (v[j].x + v[j].y) + (v[j].z + v[j].w); }
    const float mean = wave_sum(s) * (1.f / D); float s2 = 0.f;
#pragma unroll
    for (int j = 0; j < 8; ++j) { v[j] = v[j] - mean; s2 += (v[j].x * v[j].x + v[j].y * v[j].y) + (v[j].z * v[j].z + v[j].w * v[j].w); }
    const float rstd = rsqrtf(wave_sum(s2) * (1.f / D) + LN_EPS);
#pragma unroll
    for (int j = 0; j < 8; ++j) { const v4f gg = ((const v4f*)g)[lane + 64 * j], bb = ((const v4f*)b)[lane + 64 * j]; v[j] = v[j] * rstd * gg + bb; }
}
__device__ __forceinline__ void phase_ln1_router(const Params& p, int l, LAS unsigned char* lds, int wg, int G, int wave, int lane, int cnt_shift = 0) {
    const float* Y = (const float*)(p.ws + WS_Y); float* X1 = (float*)(p.ws + WS_X1); bf16* X1B = (bf16*)(p.ws + WS_X1B); int* LIST = (int*)(p.ws + WS_LIST); float* WL = (float*)(p.ws + WS_WL); unsigned* SLOT = (unsigned*)(p.ws + WS_SLOT);
    unsigned* cnt = (unsigned*)(p.ws + WS_CTL) + CW_CNT + l * 4096 + cnt_shift;
    const float* g1 = p.in[I_LN1G] + (size_t)l * D; const float* b1 = p.in[I_LN1B] + (size_t)l * D;
    const float* wr = p.in[I_WR] + (size_t)l * D * NE; const float rbias = p.in[I_RB][l * NE + lane];
    LAS float* xt = (LAS float*)lds;
    LAS float* part = (LAS float*)(lds + 65536);
    LAS unsigned* selm = (LAS unsigned*)(lds + 65536 + 16384);
    LAS float* wtm = (LAS float*)(lds + 65536 + 16384 + 16640);
    LAS unsigned char* rkm = (LAS unsigned char*)(lds + 65536 + 16384 + 16640 + 16384);
    for (int tl = wg; tl < T / 8; tl += G) {
        const size_t m = (size_t)tl * 8 + wave;
        {   v4f v[8]; ln_row(Y + m * D, g1, b1, lane, v);
            v4f* xo = (v4f*)(X1 + m * D) + lane; v2u* xb = (v2u*)(X1B + m * D) + lane;
#pragma unroll
            for (int j = 0; j < 8; ++j) { xo[64 * j] = v[j];
#if MOE_UP_FP8
                { unsigned w = 0; w = __builtin_amdgcn_cvt_pk_fp8_f32(v[j].x, v[j].y, w, false); w = __builtin_amdgcn_cvt_pk_fp8_f32(v[j].z, v[j].w, w, true); ((unsigned*)((unsigned char*)X1B + m * D))[lane + 64 * j] = w; }
#else
                { v2u o; o.x = pk2(v[j].x, v[j].y); o.y = pk2(v[j].z, v[j].w); xb[64 * j] = o; }
#endif
                *(LAS v4f*)(xt + wave * D + 4 * lane + 256 * j) = v[j]; } }
        __syncthreads();
        {   float acc[8];
#pragma unroll
            for (int r = 0; r < 8; ++r) acc[r] = 0.f;
#pragma unroll 8
            for (int d4 = 0; d4 < 64; ++d4) { const int d = wave * 256 + 4 * d4;
                const float w0 = wr[(size_t)(d + 0) * NE + lane], w1 = wr[(size_t)(d + 1) * NE + lane], w2 = wr[(size_t)(d + 2) * NE + lane], w3 = wr[(size_t)(d + 3) * NE + lane];
#pragma unroll
                for (int r = 0; r < 8; ++r) { const v4f xv = *(const LAS v4f*)(xt + r * D + d); acc[r] += xv.x * w0 + xv.y * w1 + xv.z * w2 + xv.w * w3; } }
#pragma unroll
            for (int r = 0; r < 8; ++r) part[(wave * 8 + r) * 64 + lane] = acc[r]; }
        __syncthreads();
        {   float logit = 0.f;
#pragma unroll
            for (int w = 0; w < 8; ++w) logit += part[(w * 8 + wave) * 64 + lane];
            const float s = sigmoidf_(logit), biased = s + rbias;
            const float m1 = max8(biased); const float li = (float)(lane & 7);
            const float first = min8(biased == m1 ? li : 8.f);
            const float m2 = max8(li == first ? -INFINITY : biased);
            const float gs = m1 + m2; const int myg = lane >> 3; int grank = 0;
#pragma unroll
            for (int g2 = 0; g2 < 8; ++g2) { const float o = __builtin_bit_cast(float, __builtin_amdgcn_readlane(__builtin_bit_cast(int, gs), g2 * 8)); grank += (o > gs || (o == gs && g2 < myg)) ? 1 : 0; }
            const float masked = grank < 4 ? biased : -INFINITY; int rank = 0;
#pragma unroll
            for (int e2 = 0; e2 < 64; ++e2) { const float o = __builtin_bit_cast(float, __builtin_amdgcn_readlane(__builtin_bit_cast(int, masked), e2)); rank += (o > masked || (o == masked && e2 < lane)) ? 1 : 0; }
            const float wsel = rank < 6 ? s : 0.f; const float tot = wave_sum(wsel);
            const int ri = ((tl - wg) / G) * 8 + wave;
            selm[ri * 64 + lane] = (rank < 6) ? 1u : 0u; rkm[ri * 64 + lane] = (unsigned char)rank; wtm[ri * 64 + lane] = wsel / tot * 2.5f; }
        __syncthreads();
    }
    const int nrows = ((T / 8 - wg + G - 1) / G) * 8;
    if (wave == 0) { unsigned n = 0;
        for (int r = 0; r < nrows; ++r) n += selm[r * 64 + lane];
        unsigned base = 0; if (n && !(PROBE_NOATOM && cnt_shift)) base = __hip_atomic_fetch_add(cnt + 64 * lane, n, __ATOMIC_RELAXED, __HIP_MEMORY_SCOPE_AGENT);
        selm[64 * 64 + lane] = base; }
    __syncthreads();
    for (int ri = wave; ri < nrows; ri += 8) { unsigned pos = selm[64 * 64 + lane];
        for (int r = 0; r < ri; ++r) pos += selm[r * 64 + lane];
        if (selm[ri * 64 + lane]) { const size_t m = (size_t)(wg + (ri >> 3) * G) * 8 + (ri & 7); const int rk = rkm[ri * 64 + lane];
            LIST[lane * T + pos] = (int)m; WL[lane * T + pos] = wtm[ri * 64 + lane]; SLOT[m * 8 + rk] = ((unsigned)lane << 16) | pos; } }
    __syncthreads();
}
__device__ __forceinline__ void phase_combine_ln2(const Params& p, int l, float* dst, int gw, int NGW, int lane) {
    const float* X1 = (const float*)(p.ws + WS_X1); const bf16* YE = (const bf16*)(p.ws + WS_YEXP); const unsigned* SLOT = (const unsigned*)(p.ws + WS_SLOT);
    const unsigned* cnt = (const unsigned*)(p.ws + WS_CTL) + CW_CNT + l * 4096;
    const float* g2 = p.in[I_LN2G] + (size_t)l * D; const float* b2 = p.in[I_LN2B] + (size_t)l * D;
    const int tiles = ((int)cnt[64 * lane] + 255) >> 8; const float incl = wave_scan_incl((float)tiles);
    const int toff = (int)incl - tiles;
    const int tsh = __builtin_amdgcn_readlane((int)incl, 63);
    for (int m = gw; m < T; m += NGW) {
        v4f v[8]; const v4f* xr = (const v4f*)(X1 + (size_t)m * D) + lane;
#pragma unroll
        for (int j = 0; j < 8; ++j) v[j] = xr[64 * j] * ALPHA;
#pragma unroll
        for (int k = 0; k < 7; ++k) { size_t row;
            if (k == 0) row = (size_t)tsh * 256 + m;
            else { const unsigned s = __builtin_amdgcn_readfirstlane(SLOT[(size_t)m * 8 + (k - 1)]); const int e = (int)(s >> 16); row = (size_t)__builtin_amdgcn_readlane(toff, e) * 256 + (s & 0xffffu); }
            const v2u* yr = (const v2u*)(YE + row * D) + lane;
#pragma unroll
            for (int j = 0; j < 8; ++j) { const v2u y = yr[64 * j]; v[j].x += bflo(y.x); v[j].y += bfhi(y.x); v[j].z += bflo(y.y); v[j].w += bfhi(y.y); } }
        float s = 0.f;
#pragma unroll
        for (int j = 0; j < 8; ++j) s += (v[j].x + v[j].y) + (v[j].z + v[j].w);
        const float mean = wave_sum(s) * (1.f / D); float s2 = 0.f;
#pragma unroll
        for (int j = 0; j < 8; ++j) { v[j] = v[j] - mean; s2 += (v[j].x * v[j].x + v[j].y * v[j].y) + (v[j].z * v[j].z + v[j].w * v[j].w); }
        const float rstd = rsqrtf(wave_sum(s2) * (1.f / D) + LN_EPS);
        v4f* xo = (v4f*)(dst + (size_t)m * D) + lane;
#pragma unroll
        for (int j = 0; j < 8; ++j) { const v4f gg = ((const v4f*)g2)[lane + 64 * j], bb = ((const v4f*)b2)[lane + 64 * j]; xo[64 * j] = v[j] * rstd * gg + bb; }
    }
}

constexpr int NPH = 11;
template <class S> struct DupOrder {
    S s; int n;
    __device__ __forceinline__ bool next(int i, Unit& u) const { return s.next(i >= n ? i - n : i, u); }
    __device__ __forceinline__ int row_token(int i, int r) const { return s.row_token(i >= n ? i - n : i, r); }
    __device__ __forceinline__ void a_ready(const Unit& u) const { s.a_ready(u); }
    __device__ __forceinline__ void done(const Unit& u) const { s.done(u); }
};
template <class S> __device__ __forceinline__ int count_units(const S& s) { Unit u; int n = 0; while (n < 64 && s.next(n, u)) ++n; return n; }
#define ORDER_T(k, T) typename std::conditional<PROBE_DUP == (k), DupOrder<T>, T>::type
template <class S> __device__ __forceinline__ DupOrder<S> make_order(const S& s, std::true_type) { DupOrder<S> d{s, count_units(s)}; d.n = count_units(s); return d; }
template <class S> __device__ __forceinline__ S make_order(const S& s, std::false_type) { return s; }
#define MAKE_ORDER(k, s) make_order(s, std::integral_constant<bool, PROBE_DUP == (k)>())
template <int l>
__device__ __forceinline__ void run_layer(const Params& p, LAS unsigned char* lds, const XcdBarrier& bar, int tid, int lane, int wave, int G, int wg, int gw, int NGW) {
    unsigned char* ws = p.ws;
    {
        const float* xin = (l == 0) ? p.in[I_X] : (const float*)(ws + WS_XCUR);
        float* xout = (l == NL - 1) ? p.out : (float*)(ws + WS_XCUR);
#ifndef PROBE_DUP
#define PROBE_DUP (-1)
#endif
#define IS_GEMM_PH(k) ((k) == 1 || (k) == 5 || (k) == 6 || (k) == 8 || (k) == 9)
#define REP(k) _Pragma("nounroll") for (int _r = 0; _r < ((PROBE_DUP == (k) && !IS_GEMM_PH(k)) ? 2 + (p.ph_lo >> 20) : 1); ++_r)
#ifndef PH_MASK
#define PH_MASK 0x7ff
#endif
#define RUN(k) (((PH_MASK >> (k)) & 1) && p.ph_lo <= l * NPH + (k) && l * NPH + (k) < p.ph_hi)
#define SEAM(k) do { if (l * NPH + (k) + 1 < p.ph_hi) xcd_barrier(bar); } while (0)
        if (RUN(0)) { REP(0) { phase_convert<0>(p, l, lds, gw, NGW, wave, lane);
#if defined(PROBE_CONV0)
            phase_convert<1>(p, l, lds, gw, NGW, wave, lane);
#endif
 phase_xprep(p, l, xin, lds, gw, NGW, tid, lane); } SEAM(0); }
        if (RUN(1)) { REP(1) { pg8::Gemm g{(const bf16*)(ws + WS_XB), (const bf16*)(ws + WS_WIN), T, ZC, D / 2, D / 2, D / 2}; pg8::StaticOrder S; S.init(T, ZC, G, wg);
            pg8::EpiBf16<0> E{(bf16*)(ws + WS_Z), ZC, nullptr, 0, 0, 1.f / 64.f};
            auto S2 = MAKE_ORDER(1, S); pg8::gemm_phase<pg8::EpiBf16<0>, ORDER_T(1, pg8::StaticOrder), true, true, true>(lds, g, S2, E); } SEAM(1); }
        if (RUN(2)) { REP(2) { for (int it = wg; it < 1536; it += G) { if (it < 512) gdn_pre_item(p, l, lds, it, tid, wave, lane); else if (it < 1024) ml_pre_item(p, l, lds, it - 512, tid, wave, lane); else vt_item(p, lds, it - 1024, tid); } } SEAM(2); }
        if (RUN(3)) { REP(3) { phase_mixers(p, l, lds, wg, G, tid, wave, lane, bar); } SEAM(3); }
        if (RUN(4)) { REP(4) { phase_post(p, l, gw, NGW, lane); } SEAM(4); }
        if (RUN(5)) { REP(5) { pg8::Gemm g{(const bf16*)(ws + WS_BR), (const bf16*)(ws + WS_WBR), 4 * T, 4 * D, BW, BW, BW}; MergeOrder S{G, wg};
            EpiMerge E{(const bf16*)(ws + WS_Z), (float*)(ws + WS_MTMP), (bf16*)(ws + WS_MSUM)};
            auto S2 = MAKE_ORDER(5, S); pg8::gemm_phase<EpiMerge, ORDER_T(5, MergeOrder), true, true>(lds, g, S2, E); } SEAM(5); }
        if (RUN(6)) { REP(6) { pg8::Gemm g{(const bf16*)(ws + WS_MSUM), (const bf16*)(ws + WS_WOUT), T, D, D / 2, D / 2, D / 2}; pg8::StaticOrder S; S.init(T, D, G, wg);
            EpiResid E{xin, (float*)(ws + WS_Y), 1.f / 64.f};
            auto S2 = MAKE_ORDER(6, S); pg8::gemm_phase<EpiResid, ORDER_T(6, pg8::StaticOrder), true, true, true>(lds, g, S2, E); } SEAM(6); }
        if (RUN(7)) { REP(7) { phase_ln1_router(p, l, lds, wg, G, wave, lane, (PROBE_DUP == 7 && _r == 0) ? 16384 : 0); } SEAM(7); }
        if (RUN(8)) { REP(8) { const unsigned* cnt = (const unsigned*)(ws + WS_CTL) + CW_CNT + l * 4096; MoeTab M(lds); moe_tables(M, cnt, tid, lane, wave);
            UpOrder S{M, 0}; S.n = up_order_build(M, (const int*)(ws + WS_LIST), (const float*)(ws + WS_WL), wg, G, tid);
            constexpr int KU = MOE_UP_FP8 ? D / 2 : D;
            pg8::Gemm g{(const bf16*)(ws + WS_X1B), (const bf16*)(ws + WS_WUP), T, NEX * 1024, KU, KU, KU};
            EpiGluSparse E{(LAS const float*)M.wt, (bf16*)(ws + WS_HB)};
            auto S2 = MAKE_ORDER(8, S); pg8::gemm_phase_gather<EpiGluSparse, ORDER_T(8, UpOrder), MOE_UP_FP8 != 0>(lds, g, S2, E); } SEAM(8); }
        if (RUN(9)) { REP(9) { const unsigned* cnt = (const unsigned*)(ws + WS_CTL) + CW_CNT + l * 4096; MoeTab M(lds); moe_tables(M, cnt, tid, lane, wave);
            DownOrder S{M, G, wg, 8 * M.t[65]};
            pg8::Gemm g{(const bf16*)(ws + WS_HB), (const bf16*)(ws + WS_WDN), HROWS, NEX * D, ED, ED, ED};
            EpiYexp E{(bf16*)(ws + WS_YEXP)};
            auto S2 = MAKE_ORDER(9, S); pg8::gemm_phase<EpiYexp, ORDER_T(9, DownOrder), true, true>(lds, g, S2, E); } SEAM(9); }
        if (RUN(10)) { REP(10) { phase_combine_ln2(p, l, xout, gw, NGW, lane); } SEAM(10); }
#undef RUN
#undef SEAM
    }
}
__global__ void __launch_bounds__(512, 2) fwd_kernel(Params p) {
    extern __shared__ __attribute__((aligned(16))) unsigned char lds_raw[];
    LAS unsigned char* lds = (LAS unsigned char*)lds_raw;
    const int tid = threadIdx.x, lane = tid & 63, wave = __builtin_amdgcn_readfirstlane(tid >> 6);
    const int G = gridDim.x, wg = blockIdx.x, gw = wg * 8 + wave, NGW = G * 8;
    volatile LAS unsigned* MISC = (volatile LAS unsigned*)(lds + MISC_OFF);
    if (tid < 32) MISC[tid] = 0u;
    __syncthreads();
    unsigned* ctl = (unsigned*)(p.ws + WS_CTL);
    const bool multi = (p.ph_hi - p.ph_lo) > 1;
    XcdBarrier bar; bar.bar = ctl + CW_BAR; bar.x = 0; bar.st = nullptr;
    if (multi) bar = xcd_barrier_post(ctl + CW_BAR, MISC + 8);
    run_layer<0>(p, lds, bar, tid, lane, wave, G, wg, gw, NGW);
    run_layer<1>(p, lds, bar, tid, lane, wave, G, wg, gw, NGW);
}

#ifndef MK_MULTI_LAUNCH
#define MK_MULTI_LAUNCH 0
#endif
extern "C" void kernel_launch(void* const* d_in, const int* in_sizes, int n_in, void* d_out, int out_size, void* d_ws, size_t ws_size, hipStream_t stream) {
    static int grid = 0;
    if (grid == 0) {
        if (n_in != 27 || out_size != T * D || ws_size < WS_END) { fprintf(stderr, "kernel_launch: unexpected shapes (n_in %d out %d ws %zu need %zu)\n", n_in, out_size, ws_size, (size_t)WS_END); grid = -1; return; }
        int dev = 0, cus = 0, per_cu = 0;
        if (hipGetDevice(&dev) != hipSuccess || hipDeviceGetAttribute(&cus, hipDeviceAttributeMultiprocessorCount, dev) != hipSuccess) { grid = -1; return; }
        if (hipFuncSetAttribute((const void*)fwd_kernel, hipFuncAttributeMaxDynamicSharedMemorySize, LDS_BYTES) != hipSuccess) { fprintf(stderr, "kernel_launch: hipFuncSetAttribute failed\n"); grid = -1; return; }
        if (hipOccupancyMaxActiveBlocksPerMultiprocessor(&per_cu, (const void*)fwd_kernel, 512, LDS_BYTES) != hipSuccess || per_cu < 1) { fprintf(stderr, "kernel_launch: occupancy query says %d\n", per_cu); }
        (void)hipGetLastError();
        grid = cus;
    }
    if (grid < 0) return;
    (void)hipMemsetAsync((char*)d_ws + WS_CTL, 0, CTL_ZERO_BYTES, stream);
    Params p{};
    for (int i = 0; i < 27; ++i) p.in[i] = (const float*)d_in[i];
    p.out = (float*)d_out; p.ws = (unsigned char*)d_ws;
#if MK_MULTI_LAUNCH
    for (int ph = 0; ph < NL * NPH; ++ph) { p.ph_lo = ph; p.ph_hi = ph + 1; hipLaunchKernelGGL(fwd_kernel, dim3(grid), dim3(512), LDS_BYTES, stream, p); }
#else
    p.ph_lo = 0; p.ph_hi = NL * NPH; hipLaunchKernelGGL(fwd_kernel, dim3(grid), dim3(512), LDS_BYTES, stream, p);
#endif
}
```

```cpp
#include <hip/hip_runtime.h>
#include <cstdio>
#include <cstdint>
#include <type_traits>
namespace pg8 {
#define PG8_LAS __attribute__((address_space(3)))
typedef unsigned short bf16_t;
typedef short bf16x8 __attribute__((ext_vector_type(8)));
typedef float f32x4 __attribute__((ext_vector_type(4)));
typedef unsigned u32x4 __attribute__((ext_vector_type(4)));
constexpr int BM = 256, BK = 64, HALF = 128, HTB = HALF * BK * 2  , STAGE_BYTES = 8 * HTB, NXCD = 8, WGM = 8;

__host__ __device__ __forceinline__ int lds_byte(int r, int c) { const int st = (r >> 4) * 2 + (c >> 5), rr = r & 15, cc = c & 31, ob = rr * 64 + cc * 2; return st * 1024 + (ob ^ (((ob >> 9) & 1) << 5)); }
__host__ __device__ __forceinline__ void stage_rc(int b, int& R, int& C) { const int st = b / 1024, sb = b % 1024, swz = sb ^ (((sb >> 9) & 1) << 5); R = (st >> 1) * 16 + swz / 64; C = (st & 1) * 32 + (swz % 64) / 2; }
__host__ __device__ __forceinline__ int perm32(int rho) { const int n = rho >> 4, i = rho & 15; return 8 * (i >> 2) + 4 * n + (i & 3); }

struct Unit { int pm, pn, aux; };
struct Gemm { const bf16_t* A; const bf16_t* Bt; int M, N, K, lda, ldb; };

struct StaticOrder {
    int nM, nN, nwg, G, c;
    __host__ __device__ void init(int M, int N, int G_, int c_) { nM = M / BM; nN = N / BM; nwg = nM * nN; G = G_; c = c_; }
    __host__ __device__ bool next(int i, Unit& u) const {
        const long L = (long)i * G + c; if (L >= nwg) return false;
        int wgid = (int)L; { const int q = nwg / NXCD, r = nwg % NXCD, xcd = wgid % NXCD, off = wgid / NXCD; wgid = (xcd < r ? xcd * (q + 1) : r * (q + 1) + (xcd - r) * q) + off; }
        const int nig = WGM * nN, gid = wgid / nig, fm = gid * WGM, gsz = (nM - fm) < WGM ? (nM - fm) : WGM;
        u.pm = fm + ((wgid % nig) % gsz); u.pn = (wgid % nig) / gsz; return true;
    }
    __device__ __forceinline__ void a_ready(const Unit&) const {}
    __device__ __forceinline__ void done(const Unit&) const {}
};

__device__ __forceinline__ unsigned cvt_pk_bf16(float lo, float hi) { unsigned r; asm volatile("v_cvt_pk_bf16_f32 %0, %1, %2" : "=v"(r) : "v"(lo), "v"(hi)); return r; }
typedef float f32x2 __attribute__((ext_vector_type(2)));
__device__ __forceinline__ f32x2 gelu_pk(f32x2 v) {
    const f32x2 av = __builtin_elementwise_abs(v), d = av * 0.2316418882f + 1.0f;
    f32x2 t; t.x = __builtin_amdgcn_rcpf(d.x); t.y = __builtin_amdgcn_rcpf(d.y);
    f32x2 q = t * 0.5307027145f + (-0.7265760135f); q = q * t + 0.7107068705f; q = q * t + (-0.142248368f); q = q * t + 0.127414796f; q = q * t;
    const f32x2 s = (v * v) * (-0.72134752044f);
    f32x2 e; e.x = __builtin_amdgcn_exp2f(s.x); e.y = __builtin_amdgcn_exp2f(s.y);
    const f32x2 m = v * (q * e), r = v - m;
    f32x2 o; o.x = v.x < 0.f ? m.x : r.x; o.y = v.y < 0.f ? m.y : r.y; return o;
}

template <int ACT  > struct EpiBf16 {
    static constexpr bool PERM = true, AFTER_DRAIN = false; static constexpr int MID = 0; static_assert(ACT == 0 || ACT == 1, "EpiBf16: ACT is 0 (none) or 1 (gelu_pk)");
    bf16_t* O; int ldc; const float* bias; int split_cols; size_t split_stride; float scale0;
    __device__ __forceinline__ void operator()(const f32x4 (&acc)[2][2][4][2], const Unit& u, int wr, int wc, int fr, int fq) const {
        const int row0 = u.pm * BM + wr * 64 + fr; int colt = u.pn * BM; bf16_t* base = O;
        float sc = scale0; if (split_cols) { const int t = colt / split_cols; base += (size_t)t * split_stride; colt -= t * split_cols; if (t != 0) sc = 1.f; }
        const int col0 = colt + wc * 32 + 8 * fq, bcol0 = u.pn * BM + wc * 32 + 8 * fq;
        f32x4 bv[2][2];
#pragma unroll
        for (int bj = 0; bj < 2; ++bj)
#pragma unroll
            for (int n = 0; n < 2; ++n) bv[bj][n] = bias ? *(const f32x4*)(bias + bcol0 + bj * HALF + 4 * n) : (f32x4){0.f, 0.f, 0.f, 0.f};
#pragma unroll
        for (int ai = 0; ai < 2; ++ai)
#pragma unroll
            for (int m = 0; m < 4; ++m) { bf16_t* rowp = base + (size_t)(row0 + ai * HALF + m * 16) * ldc + col0;
#pragma unroll
                for (int bj = 0; bj < 2; ++bj) { f32x4 v0 = acc[ai][bj][m][0] + bv[bj][0], v1 = acc[ai][bj][m][1] + bv[bj][1];
                    if (ACT == 1) { f32x2 a = gelu_pk((f32x2){v0[0], v0[1]}), b = gelu_pk((f32x2){v0[2], v0[3]}), c = gelu_pk((f32x2){v1[0], v1[1]}), d = gelu_pk((f32x2){v1[2], v1[3]});
                        v0 = (f32x4){a.x, a.y, b.x, b.y}; v1 = (f32x4){c.x, c.y, d.x, d.y}; }
                    v0 = v0 * sc; v1 = v1 * sc; u32x4 w; w.x = cvt_pk_bf16(v0[0], v0[1]); w.y = cvt_pk_bf16(v0[2], v0[3]); w.z = cvt_pk_bf16(v1[0], v1[1]); w.w = cvt_pk_bf16(v1[2], v1[3]);
                    *(u32x4*)(rowp + bj * HALF) = w; } }
    }
};

typedef int i32x8 __attribute__((ext_vector_type(8)));
__device__ __forceinline__ i32x8 cat8(const bf16x8 a, const bf16x8 b) { typedef int i32x4 __attribute__((ext_vector_type(4))); const i32x4 x = __builtin_bit_cast(i32x4, a), y = __builtin_bit_cast(i32x4, b); return (i32x8){x[0], x[1], x[2], x[3], y[0], y[1], y[2], y[3]}; }
__device__ __forceinline__ bf16x8 lo8(const i32x8 v) { typedef int i32x4 __attribute__((ext_vector_type(4))); return __builtin_bit_cast(bf16x8, __builtin_shufflevector(v, v, 0, 1, 2, 3)); }
__device__ __forceinline__ bf16x8 hi8(const i32x8 v) { typedef int i32x4 __attribute__((ext_vector_type(4))); return __builtin_bit_cast(bf16x8, __builtin_shufflevector(v, v, 4, 5, 6, 7)); }
template <class Epi, class Sched, bool ALIGN_EPI = false, bool SP2 = false, bool FP8 = false>
__device__ __forceinline__ void gemm_phase(PG8_LAS unsigned char* lds, const Gemm g, const Sched& S, const Epi& E) {
    const int tid = threadIdx.x, wid = __builtin_amdgcn_readfirstlane(tid >> 6), lane = tid & 63, wr = wid >> 2, wc = wid & 3, fr = lane & 15, fq = lane >> 4;
    const int K = g.K, nt = K / BK;
    unsigned voffA[2], voffB[2];
#pragma unroll
    for (int i = 0; i < 2; ++i) { int R, C; stage_rc(tid * 16 + i * 8192, R, C); const int Rb = Epi::PERM ? ((R & ~31) + perm32(R & 31)) : R;
        voffA[i] = (unsigned)(R * g.lda + C) * 2u; voffB[i] = (unsigned)(Rb * g.ldb + C) * 2u; }
    const size_t kstep = (size_t)(BK * 2);
    const size_t hstepA = (size_t)HALF * g.lda * 2, hstepB = (size_t)HALF * g.ldb * 2;
    const size_t tstepA = 2 * hstepA, tstepB = 2 * hstepB;
    const unsigned ldsw = (unsigned)wid * 1024u;
    const int aoff = lds_byte(wr * 64 + fr, fq * 8), boff = lds_byte(wc * 32 + fr, fq * 8);
#define PG8_SA(b, h) (((b) * 2 + (h)) * HTB)
#define PG8_SB(b, h) ((4 + (b) * 2 + (h)) * HTB)
#define PG8_STAGE(bufoff, gbase, voff) do { _Pragma("unroll") for (int _i = 0; _i < 2; ++_i) \
        __builtin_amdgcn_global_load_lds((const unsigned*)((const char*)(gbase) + (voff)[_i]), (PG8_LAS unsigned*)(lds + (bufoff) + ldsw + _i * 8192), 16, 0, 0); } while (0)
#define PG8_LDA(dst, b, h) do { _Pragma("unroll") for (int m = 0; m < 4; ++m) { if constexpr (FP8) dst##8[m] = cat8(*(const PG8_LAS bf16x8*)(lds + PG8_SA(b, h) + aoff + m * 2048), *(const PG8_LAS bf16x8*)(lds + PG8_SA(b, h) + aoff + m * 2048 + 1024)); \
        else { _Pragma("unroll") for (int k = 0; k < 2; ++k) dst[m][k] = *(const PG8_LAS bf16x8*)(lds + PG8_SA(b, h) + aoff + m * 2048 + k * 1024); } } } while (0)
#define PG8_LDB(dst, b, h) do { _Pragma("unroll") for (int n = 0; n < 2; ++n) { if constexpr (FP8) dst##8[n] = cat8(*(const PG8_LAS bf16x8*)(lds + PG8_SB(b, h) + boff + n * 2048), *(const PG8_LAS bf16x8*)(lds + PG8_SB(b, h) + boff + n * 2048 + 1024)); \
        else { _Pragma("unroll") for (int k = 0; k < 2; ++k) dst[n][k] = *(const PG8_LAS bf16x8*)(lds + PG8_SB(b, h) + boff + n * 2048 + k * 1024); } } } while (0)
#define PG8_MMA(ai, bj, At, Bt) do { __builtin_amdgcn_s_setprio(1); _Pragma("unroll") for (int m = 0; m < 4; ++m) _Pragma("unroll") for (int n = 0; n < 2; ++n) { \
        if constexpr (FP8) asm volatile("v_mfma_scale_f32_16x16x128_f8f6f4 %0, %1, %2, %0, %3, %3 op_sel_hi:[0,0,0]" : "+v"(acc[ai][bj][m][n]) : "v"(Bt##8[n]), "v"(At##8[m]), "v"(fp8_unit_scale)); \
        else { _Pragma("unroll") for (int k = 0; k < 2; ++k) acc[ai][bj][m][n] = __builtin_amdgcn_mfma_f32_16x16x32_bf16(Bt[n][k], At[m][k], acc[ai][bj][m][n], 0, 0, 0); } } __builtin_amdgcn_s_setprio(0); } while (0)
#define PG8_WAIT_V(n) asm volatile("s_waitcnt vmcnt(" #n ")" ::: "memory")
#define PG8_WAIT_L(n) asm volatile("s_waitcnt lgkmcnt(" #n ")" ::: "memory")
#define PG8_BAR __builtin_amdgcn_s_barrier()
#define PG8_SCHED __builtin_amdgcn_sched_barrier(0)
    Unit cur, nxt; int ui = 0;
    if (!S.next(0, cur)) return;
    f32x4 acc[2][2][4][2];
#pragma unroll
    for (int a = 0; a < 2; ++a)
#pragma unroll
        for (int b = 0; b < 2; ++b)
#pragma unroll
            for (int m = 0; m < 4; ++m)
#pragma unroll
                for (int n = 0; n < 2; ++n) acc[a][b][m][n] = (f32x4){0.f, 0.f, 0.f, 0.f};
    int fp8_unit_scale = 0x7F7F7F7F; asm volatile("" : "+v"(fp8_unit_scale));
    bf16x8 At[4][2], B0[2][2], B1[2][2];
    i32x8 At8[4], B08[2], B18[2];
    const char* cA = (const char*)g.A + (size_t)cur.pm * tstepA; const char* cB = (const char*)g.Bt + (size_t)cur.pn * tstepB;
    S.a_ready(cur);
    if constexpr (SP2) {
        PG8_STAGE(PG8_SB(0, 0), cB, voffB); PG8_STAGE(PG8_SB(0, 1), cB + hstepB, voffB); PG8_STAGE(PG8_SA(0, 0), cA, voffA); PG8_STAGE(PG8_SA(0, 1), cA + hstepA, voffA);
        if (wr == 1) PG8_BAR;
        PG8_WAIT_V(2); PG8_BAR;
        PG8_STAGE(PG8_SB(1, 0), cB + kstep, voffB); PG8_STAGE(PG8_SA(1, 0), cA + kstep, voffA); PG8_STAGE(PG8_SB(1, 1), cB + hstepB + kstep, voffB);
        PG8_WAIT_V(6); PG8_BAR;
    } else {
        PG8_STAGE(PG8_SB(0, 0), cB, voffB); PG8_STAGE(PG8_SA(0, 0), cA, voffA); PG8_STAGE(PG8_SB(0, 1), cB + hstepB, voffB); PG8_STAGE(PG8_SA(0, 1), cA + hstepA, voffA);
        if (wr == 1) PG8_BAR;
        PG8_WAIT_V(4); PG8_BAR;
        PG8_STAGE(PG8_SB(1, 0), cB + kstep, voffB); PG8_STAGE(PG8_SA(1, 0), cA + kstep, voffA); PG8_STAGE(PG8_SB(1, 1), cB + hstepB + kstep, voffB);
        PG8_WAIT_V(6); PG8_BAR;
    }
    for (;;) {
        const bool has_next = S.next(ui + 1, nxt);
        const char* nA = has_next ? (const char*)g.A + (size_t)nxt.pm * tstepA : cA; const char* nB = has_next ? (const char*)g.Bt + (size_t)nxt.pn * tstepB : cB;
        for (int t = 0; t < nt; t += 2) {
            const bool last = (t == nt - 2);
            const char* a1 = cA + (size_t)(t + 1) * kstep;
            const char* a2 = last ? nA : cA + (size_t)(t + 2) * kstep; const char* b2 = last ? nB : cB + (size_t)(t + 2) * kstep;
            const char* a3 = a2 + kstep; const char* b3 = b2 + kstep;
            if (last && has_next) S.a_ready(nxt);
            if constexpr (SP2) {
            if constexpr (Epi::MID > 0) { if (t != 0 && (t % Epi::MID) == 0) { PG8_SCHED; E.mid(acc, cur, t / Epi::MID, wr, wc, fr, fq); PG8_SCHED; } }
            PG8_LDB(B0, 0, 0); PG8_LDB(B1, 0, 1); PG8_SCHED; PG8_LDA(At, 0, 0); PG8_STAGE(PG8_SA(1, 1), a1 + hstepA, voffA);
            PG8_WAIT_V(8); PG8_WAIT_L(0); PG8_BAR; PG8_MMA(0, 0, At, B0); PG8_MMA(0, 1, At, B1); PG8_BAR; PG8_SCHED;
            PG8_LDA(At, 0, 1); PG8_STAGE(PG8_SB(0, 0), b2, voffB); PG8_STAGE(PG8_SB(0, 1), b2 + hstepB, voffB); PG8_STAGE(PG8_SA(0, 0), a2, voffA);
            PG8_WAIT_V(8); PG8_WAIT_L(0); PG8_BAR; PG8_MMA(1, 0, At, B0); PG8_MMA(1, 1, At, B1); PG8_BAR; PG8_SCHED;
            PG8_LDB(B0, 1, 0); PG8_LDB(B1, 1, 1); PG8_SCHED; PG8_LDA(At, 1, 0); PG8_STAGE(PG8_SA(0, 1), a2 + hstepA, voffA);
            PG8_WAIT_V(8); PG8_WAIT_L(0); PG8_BAR; PG8_MMA(0, 0, At, B0); PG8_MMA(0, 1, At, B1); PG8_BAR; PG8_SCHED;
            PG8_LDA(At, 1, 1); PG8_STAGE(PG8_SB(1, 0), b3, voffB); PG8_STAGE(PG8_SB(1, 1), b3 + hstepB, voffB); PG8_STAGE(PG8_SA(1, 0), a3, voffA);
            PG8_WAIT_V(8); PG8_WAIT_L(0); PG8_BAR; PG8_MMA(1, 0, At, B0); PG8_MMA(1, 1, At, B1); PG8_BAR; PG8_SCHED;
            } else {
            PG8_LDB(B0, 0, 0); PG8_SCHED; PG8_LDA(At, 0, 0); PG8_STAGE(PG8_SA(1, 1), a1 + hstepA, voffA);
            PG8_WAIT_L(8); PG8_BAR; PG8_WAIT_L(0); PG8_MMA(0, 0, At, B0); PG8_BAR; PG8_SCHED;
            PG8_LDB(B1, 0, 1); PG8_STAGE(PG8_SB(0, 0), b2, voffB);
            PG8_BAR; PG8_WAIT_L(0); PG8_MMA(0, 1, At, B1); PG8_BAR;
            PG8_LDA(At, 0, 1); PG8_STAGE(PG8_SA(0, 0), a2, voffA);
            PG8_BAR; PG8_WAIT_L(0); PG8_MMA(1, 0, At, B0); PG8_BAR; PG8_SCHED;
            PG8_STAGE(PG8_SB(0, 1), b2 + hstepB, voffB);
            PG8_WAIT_V(6); PG8_BAR; PG8_MMA(1, 1, At, B1); PG8_BAR;
            PG8_LDB(B0, 1, 0); PG8_SCHED; PG8_LDA(At, 1, 0); PG8_STAGE(PG8_SA(0, 1), a2 + hstepA, voffA);
            PG8_WAIT_L(8); PG8_BAR; PG8_WAIT_L(0); PG8_MMA(0, 0, At, B0); PG8_BAR; PG8_SCHED;
            PG8_LDB(B1, 1, 1); PG8_STAGE(PG8_SB(1, 0), b3, voffB);
            PG8_BAR; PG8_WAIT_L(0); PG8_MMA(0, 1, At, B1); PG8_BAR;
            PG8_LDA(At, 1, 1); PG8_STAGE(PG8_SA(1, 0), a3, voffA);
            PG8_BAR; PG8_WAIT_L(0); PG8_MMA(1, 0, At, B0); PG8_BAR; PG8_SCHED;
            PG8_STAGE(PG8_SB(1, 1), b3 + hstepB, voffB);
            PG8_WAIT_V(6); PG8_BAR; PG8_MMA(1, 1, At, B1); PG8_BAR;
            }
        }
        if constexpr (ALIGN_EPI) { if (wr == 0) PG8_BAR; }
        if constexpr (FP8) asm volatile("s_nop 7\n\ts_nop 7" ::: "memory");
        if constexpr (!Epi::AFTER_DRAIN) { E(acc, cur, wr, wc, fr, fq); S.done(cur); }
        if (!has_next) break;
#pragma unroll
        for (int a = 0; a < 2; ++a)
#pragma unroll
            for (int b = 0; b < 2; ++b)
#pragma unroll
                for (int m = 0; m < 4; ++m)
#pragma unroll
                    for (int n = 0; n < 2; ++n) acc[a][b][m][n] = (f32x4){0.f, 0.f, 0.f, 0.f};
        cur = nxt; cA = nA; cB = nB; ++ui;
        if constexpr (ALIGN_EPI) { if (wr == 1) PG8_BAR; }
    }
    PG8_WAIT_V(0);
    if constexpr (!ALIGN_EPI) { if (wr == 0) PG8_BAR; }
    PG8_BAR;
    if constexpr (Epi::AFTER_DRAIN) { E.fused(acc, cur, wr, wc, fr, fq, lds, wid, lane); S.done(cur); }
#undef PG8_SA
#undef PG8_SB
#undef PG8_STAGE
#undef PG8_LDA
#undef PG8_LDB
#undef PG8_MMA
#undef PG8_WAIT_V
#undef PG8_WAIT_L
#undef PG8_BAR
#undef PG8_SCHED
}
template <class Epi, class Sched, bool FP8 = false>
__device__ __forceinline__ void gemm_phase_gather(PG8_LAS unsigned char* lds, const Gemm g, const Sched& S, const Epi& E) {
    const int tid = threadIdx.x, wid = __builtin_amdgcn_readfirstlane(tid >> 6), lane = tid & 63, wr = wid >> 2, wc = wid & 3, fr = lane & 15, fq = lane >> 4;
    const int K = g.K, nt = K / BK;
    unsigned voffB[2]; int RA[2], CA[2];
#pragma unroll
    for (int i = 0; i < 2; ++i) { int R, C; stage_rc(tid * 16 + i * 8192, R, C); const int Rb = Epi::PERM ? ((R & ~31) + perm32(R & 31)) : R;
        RA[i] = R; CA[i] = C; voffB[i] = (unsigned)(Rb * g.ldb + C) * 2u; }
    const size_t kstep = (size_t)(BK * 2);
    const size_t hstepB = (size_t)HALF * g.ldb * 2, tstepB = 2 * hstepB;
    const unsigned ldsw = (unsigned)wid * 1024u;
    const int aoff = lds_byte(wr * 64 + fr, fq * 8), boff = lds_byte(wc * 32 + fr, fq * 8);
#define PG8_SA(b, h) (((b) * 2 + (h)) * HTB)
#define PG8_SB(b, h) ((4 + (b) * 2 + (h)) * HTB)
#define PG8_STAGE(bufoff, gbase, voff) do { _Pragma("unroll") for (int _i = 0; _i < 2; ++_i) \
        __builtin_amdgcn_global_load_lds((const unsigned*)((const char*)(gbase) + (voff)[_i]), (PG8_LAS unsigned*)(lds + (bufoff) + ldsw + _i * 8192), 16, 0, 0); } while (0)
#define PG8_LDA(dst, b, h) do { _Pragma("unroll") for (int m = 0; m < 4; ++m) { if constexpr (FP8) dst##8[m] = cat8(*(const PG8_LAS bf16x8*)(lds + PG8_SA(b, h) + aoff + m * 2048), *(const PG8_LAS bf16x8*)(lds + PG8_SA(b, h) + aoff + m * 2048 + 1024)); \
        else { _Pragma("unroll") for (int k = 0; k < 2; ++k) dst[m][k] = *(const PG8_LAS bf16x8*)(lds + PG8_SA(b, h) + aoff + m * 2048 + k * 1024); } } } while (0)
#define PG8_LDB(dst, b, h) do { _Pragma("unroll") for (int n = 0; n < 2; ++n) { if constexpr (FP8) dst##8[n] = cat8(*(const PG8_LAS bf16x8*)(lds + PG8_SB(b, h) + boff + n * 2048), *(const PG8_LAS bf16x8*)(lds + PG8_SB(b, h) + boff + n * 2048 + 1024)); \
        else { _Pragma("unroll") for (int k = 0; k < 2; ++k) dst[n][k] = *(const PG8_LAS bf16x8*)(lds + PG8_SB(b, h) + boff + n * 2048 + k * 1024); } } } while (0)
#define PG8_MMA(ai, bj, At, Bt) do { __builtin_amdgcn_s_setprio(1); _Pragma("unroll") for (int m = 0; m < 4; ++m) _Pragma("unroll") for (int n = 0; n < 2; ++n) { \
        if constexpr (FP8) asm volatile("v_mfma_scale_f32_16x16x128_f8f6f4 %0, %1, %2, %0, %3, %3 op_sel_hi:[0,0,0]" : "+v"(acc[ai][bj][m][n]) : "v"(Bt##8[n]), "v"(At##8[m]), "v"(fp8_unit_scale)); \
        else { _Pragma("unroll") for (int k = 0; k < 2; ++k) acc[ai][bj][m][n] = __builtin_amdgcn_mfma_f32_16x16x32_bf16(Bt[n][k], At[m][k], acc[ai][bj][m][n], 0, 0, 0); } } __builtin_amdgcn_s_setprio(0); } while (0)
#define PG8_WAIT_V(n) asm volatile("s_waitcnt vmcnt(" #n ")" ::: "memory")
#define PG8_WAIT_L(n) asm volatile("s_waitcnt lgkmcnt(" #n ")" ::: "memory")
#define PG8_BAR __builtin_amdgcn_s_barrier()
#define PG8_SCHED __builtin_amdgcn_sched_barrier(0)
#define PG8_ROWS(dst, ui_) do { _Pragma("unroll") for (int _h = 0; _h < 2; ++_h) _Pragma("unroll") for (int _i = 0; _i < 2; ++_i) \
        dst[_h][_i] = (unsigned)S.row_token((ui_), _h * HALF + RA[_i]) * (unsigned)(g.lda * 2) + (unsigned)(CA[_i] * 2); } while (0)
    Unit cur, nxt; int ui = 0;
    if (!S.next(0, cur)) return;
    f32x4 acc[2][2][4][2];
#pragma unroll
    for (int a = 0; a < 2; ++a)
#pragma unroll
        for (int b = 0; b < 2; ++b)
#pragma unroll
            for (int m = 0; m < 4; ++m)
#pragma unroll
                for (int n = 0; n < 2; ++n) acc[a][b][m][n] = (f32x4){0.f, 0.f, 0.f, 0.f};
    int fp8_unit_scale = 0x7F7F7F7F; asm volatile("" : "+v"(fp8_unit_scale));
    bf16x8 At[4][2], B0[2][2], B1[2][2];
    i32x8 At8[4], B08[2], B18[2];
    unsigned offC[2][2];
    PG8_ROWS(offC, 0);
    const char* gA = (const char*)g.A;
    const char* cB = (const char*)g.Bt + (size_t)cur.pn * tstepB;
    PG8_STAGE(PG8_SB(0, 0), cB, voffB); PG8_STAGE(PG8_SB(0, 1), cB + hstepB, voffB); PG8_STAGE(PG8_SA(0, 0), gA, offC[0]); PG8_STAGE(PG8_SA(0, 1), gA, offC[1]);
    if (wr == 1) PG8_BAR;
    PG8_WAIT_V(2); PG8_BAR;
    PG8_STAGE(PG8_SB(1, 0), cB + kstep, voffB); PG8_STAGE(PG8_SA(1, 0), gA + kstep, offC[0]); PG8_STAGE(PG8_SB(1, 1), cB + hstepB + kstep, voffB);
    PG8_WAIT_V(6); PG8_BAR;
    for (;;) {
        const bool has_next = S.next(ui + 1, nxt);
        const char* nB = has_next ? (const char*)g.Bt + (size_t)nxt.pn * tstepB : cB;
        for (int t = 0; t < nt; t += 2) {
            const bool last = (t == nt - 2);
            const char* a1 = gA + (size_t)(t + 1) * kstep;
            const char* a2 = last ? gA : gA + (size_t)(t + 2) * kstep; const char* b2 = last ? nB : cB + (size_t)(t + 2) * kstep;
            const char* a3 = a2 + kstep; const char* b3 = b2 + kstep;
            PG8_LDB(B0, 0, 0); PG8_LDB(B1, 0, 1); PG8_SCHED; PG8_LDA(At, 0, 0); PG8_STAGE(PG8_SA(1, 1), a1, offC[1]);
            if (last && has_next) { PG8_ROWS(offC, ui + 1); }
            PG8_WAIT_V(8); PG8_WAIT_L(0); PG8_BAR; PG8_MMA(0, 0, At, B0); PG8_MMA(0, 1, At, B1); PG8_BAR; PG8_SCHED;
            PG8_LDA(At, 0, 1); PG8_STAGE(PG8_SB(0, 0), b2, voffB); PG8_STAGE(PG8_SB(0, 1), b2 + hstepB, voffB); PG8_STAGE(PG8_SA(0, 0), a2, offC[0]);
            PG8_WAIT_V(8); PG8_WAIT_L(0); PG8_BAR; PG8_MMA(1, 0, At, B0); PG8_MMA(1, 1, At, B1); PG8_BAR; PG8_SCHED;
            PG8_LDB(B0, 1, 0); PG8_LDB(B1, 1, 1); PG8_SCHED; PG8_LDA(At, 1, 0); PG8_STAGE(PG8_SA(0, 1), a2, offC[1]);
            PG8_WAIT_V(8); PG8_WAIT_L(0); PG8_BAR; PG8_MMA(0, 0, At, B0); PG8_MMA(0, 1, At, B1); PG8_BAR; PG8_SCHED;
            PG8_LDA(At, 1, 1); PG8_STAGE(PG8_SB(1, 0), b3, voffB); PG8_STAGE(PG8_SB(1, 1), b3 + hstepB, voffB); PG8_STAGE(PG8_SA(1, 0), a3, offC[0]);
            PG8_WAIT_V(8); PG8_WAIT_L(0); PG8_BAR; PG8_MMA(1, 0, At, B0); PG8_MMA(1, 1, At, B1); PG8_BAR; PG8_SCHED;
        }
        if (wr == 0) PG8_BAR;
        if constexpr (FP8) asm volatile("s_nop 7\n\ts_nop 7" ::: "memory");
        E(acc, cur, wr, wc, fr, fq); S.done(cur);
        if (!has_next) break;
#pragma unroll
        for (int a = 0; a < 2; ++a)
#pragma unroll
            for (int b = 0; b < 2; ++b)
#pragma unroll
                for (int m = 0; m < 4; ++m)
#pragma unroll
                    for (int n = 0; n < 2; ++n) acc[a][b][m][n] = (f32x4){0.f, 0.f, 0.f, 0.f};
        cur = nxt; cB = nB; ++ui;
        if (wr == 1) PG8_BAR;
    }
    PG8_WAIT_V(0);
    PG8_BAR;
#undef PG8_ROWS
#undef PG8_SA
#undef PG8_SB
#undef PG8_STAGE
#undef PG8_LDA
#undef PG8_LDB
#undef PG8_MMA
#undef PG8_WAIT_V
#undef PG8_WAIT_L
#undef PG8_BAR
#undef PG8_SCHED
}
}

#ifndef MOE_UP_FP8
#define MOE_UP_FP8 1
#endif
#ifndef PROBE_NOATOM
#define PROBE_NOATOM 0
#endif
constexpr int T = 8192, D = 2048, NL = 2, BW = 512, ZC = 14336, INC = 14352;
constexpr int NE = 64, NEX = 65  , ED = 512;
constexpr int BRW = 4 * BW;
constexpr int HK = NEX * ED;
constexpr float ALPHA = 1.41421356237f;
constexpr float LN_EPS = 1e-5f;
constexpr float UPSC = MOE_UP_FP8 ? (1.f / 64.f) : 1.f;
constexpr int ZC_SBQ = 0, ZC_SBK = 512, ZC_SBV = 1024, ZC_GMU = 1536, ZC_GMV = 2048, ZC_GDN = 2560, ZC_GDNG = 4096,
              ZC_MLQ = 4608, ZC_MLK = 4864, ZC_MLV = 5120, ZC_MLO = 5632, ZC_GATE = 6144;

#define GAS __attribute__((address_space(1)))
#define LAS __attribute__((address_space(3)))
typedef unsigned short bf16;
typedef unsigned v4u __attribute__((ext_vector_type(4)));
typedef unsigned v2u __attribute__((ext_vector_type(2)));
typedef float v4f __attribute__((ext_vector_type(4)));
typedef float v2f __attribute__((ext_vector_type(2)));
#define LDS_WAIT() asm volatile("s_waitcnt lgkmcnt(0)" ::: "memory")
#define LDS_BAR() do { asm volatile("s_waitcnt lgkmcnt(0)" ::: "memory"); __builtin_amdgcn_s_barrier(); asm volatile("" ::: "memory"); } while (0)

constexpr size_t MiB = 1u << 20;
constexpr size_t WS_CTL = 0, CTL_ZERO_BYTES = 1 * MiB;
constexpr size_t WS_WIN = 2 * MiB, WS_WBR = 58 * MiB, WS_WOUT = 66 * MiB, WS_WUP = 74 * MiB, WS_WDN = 334 * MiB;
constexpr size_t WS_XB = 464 * MiB, WS_SMALL = 496 * MiB, WS_EG = 497 * MiB, WS_BETA = WS_EG + 256 * 1024, WS_COMB = 498 * MiB;
constexpr size_t WS_Z = 500 * MiB, WS_GQ = 724 * MiB, WS_GK = 740 * MiB, WS_GV = 756 * MiB, WS_GO = 772 * MiB, WS_HO = 788 * MiB;
constexpr size_t WS_BR = 804 * MiB, WS_MTMP = 836 * MiB, WS_MSUM = 900 * MiB, WS_Y = 932 * MiB, WS_X1 = 996 * MiB, WS_X1B = 1060 * MiB;
constexpr size_t WS_XCUR = 1092 * MiB, WS_HB = 1156 * MiB, WS_YEXP = 1236 * MiB, WS_LIST = 1524 * MiB, WS_WL = 1526 * MiB, WS_SLOT = 1528 * MiB, WS_MQ = 1530 * MiB, WS_MS = 1534 * MiB, WS_MK = 1538 * MiB, WS_MV = 1542 * MiB, WS_MFL = 1552 * MiB, WS_HDEN = WS_MFL + 65536, WS_VT = 1553 * MiB, WS_END = 1561 * MiB;
constexpr size_t WS_GU = WS_GQ, WS_GNW = WS_GK, WS_GQG = WS_GK + 8 * MiB, WS_GKT = WS_GV, WS_GAT = WS_GV + 8 * MiB, WS_GDL = WS_GV + 12 * MiB;
constexpr int HROWS = 73728;
static_assert(WS_HB + (size_t)HROWS * ED * 2 <= WS_YEXP && WS_YEXP + (size_t)HROWS * D * 2 <= WS_LIST, "ws map (moe)");
static_assert(WS_WIN + (size_t)ZC * D * 2 <= WS_WBR && WS_WUP + (size_t)NEX * 1024 * D * 2 <= WS_WDN && WS_WDN + (size_t)D * HK * 2 <= WS_XB, "ws map (weights)");
static_assert(WS_Z + (size_t)T * ZC * 2 <= WS_GQ, "ws map (acts)");
constexpr int CW_BAR = 4096, CW_CNT = 16384;
constexpr int TAB_OFF = 131072 + 1024;
constexpr int LDS_BYTES = 163840, MISC_OFF = 131072 + 320;

__device__ __forceinline__ float bflo(unsigned w) { return __uint_as_float(w << 16); }
__device__ __forceinline__ float bfhi(unsigned w) { return __uint_as_float(w & 0xffff0000u); }
__device__ __forceinline__ unsigned f2bf(float f) { unsigned u = __float_as_uint(f); return (u + 0x7fffu + ((u >> 16) & 1u)) >> 16; }
__device__ __forceinline__ unsigned pk2(float lo, float hi) { return f2bf(lo) | (f2bf(hi) << 16); }
template <int CTRL> __device__ __forceinline__ float dpp(float x) { return __builtin_bit_cast(float, __builtin_amdgcn_mov_dpp(__builtin_bit_cast(int, x), CTRL, 0xf, 0xf, true)); }
__device__ __forceinline__ float sum4(float x) { x += dpp<0xB1>(x); x += dpp<0x4E>(x); return x; }
__device__ __forceinline__ float sum8(float x) { x = sum4(x); x += dpp<0x141>(x); return x; }
__device__ __forceinline__ float sum16(float x) { x = sum8(x); x += dpp<0x140>(x); return x; }
__device__ __forceinline__ float wave_sum(float x) { x = sum16(x); x += __shfl_xor(x, 16); x += __shfl_xor(x, 32); return x; }
__device__ __forceinline__ float max8(float x) { x = fmaxf(x, dpp<0xB1>(x)); x = fmaxf(x, dpp<0x4E>(x)); x = fmaxf(x, dpp<0x141>(x)); return x; }
__device__ __forceinline__ float min8(float x) { x = fminf(x, dpp<0xB1>(x)); x = fminf(x, dpp<0x4E>(x)); x = fminf(x, dpp<0x141>(x)); return x; }
__device__ __forceinline__ float wave_scan_incl(float v) {
    v += __builtin_bit_cast(float, __builtin_amdgcn_update_dpp(0, __builtin_bit_cast(int, v), 0x111, 0xf, 0xf, true));
    v += __builtin_bit_cast(float, __builtin_amdgcn_update_dpp(0, __builtin_bit_cast(int, v), 0x112, 0xf, 0xf, true));
    v += __builtin_bit_cast(float, __builtin_amdgcn_update_dpp(0, __builtin_bit_cast(int, v), 0x114, 0xf, 0xf, true));
    v += __builtin_bit_cast(float, __builtin_amdgcn_update_dpp(0, __builtin_bit_cast(int, v), 0x118, 0xf, 0xf, true));
    v += __builtin_bit_cast(float, __builtin_amdgcn_update_dpp(0, __builtin_bit_cast(int, v), 0x142, 0xa, 0xf, false));
    v += __builtin_bit_cast(float, __builtin_amdgcn_update_dpp(0, __builtin_bit_cast(int, v), 0x143, 0xc, 0xf, false));
    return v;
}
__device__ __forceinline__ float sigmoidf_(float x) { return 1.f / (1.f + __expf(-x)); }
__device__ __forceinline__ float siluf_(float x) { return x / (1.f + __expf(-x)); }
__device__ __forceinline__ float softplusf_(float x) { return fmaxf(x, 0.f) + __logf(1.f + __expf(-fabsf(x))); }
__device__ __forceinline__ float gelu_tanh(float x) { const float y = 0.7978845608f * (x + 0.044715f * x * x * x); const float t = 1.f - 2.f / (__expf(2.f * y) + 1.f); return 0.5f * x * (1.f + t); }
__device__ __forceinline__ void unpack8(const v4u r, float (&f)[8]) { f[0] = bflo(r.x); f[1] = bfhi(r.x); f[2] = bflo(r.y); f[3] = bfhi(r.y); f[4] = bflo(r.z); f[5] = bfhi(r.z); f[6] = bflo(r.w); f[7] = bfhi(r.w); }
#define XB_TMO      128
#define XB_XCNT(j)  (256  + 64 * (j))
#define XB_XSUB(j)  (1280 + 64 * (j))
#define XB_XGEN(j)  (2304 + 64 * (j))
#define XB_TOP      3328
#define XB_TOPGEN   3392
#define XCD_BAR_WORDS 3456
#define XB_SPIN_CAP (1u << 18)

__device__ __forceinline__ unsigned xb_ld(unsigned* p)              { return __hip_atomic_load(p, __ATOMIC_RELAXED, __HIP_MEMORY_SCOPE_AGENT); }
__device__ __forceinline__ unsigned xb_add(unsigned* p, unsigned v) { return __hip_atomic_fetch_add(p, v, __ATOMIC_RELAXED, __HIP_MEMORY_SCOPE_AGENT); }
__device__ __forceinline__ unsigned xb_xcc_id() { return (unsigned)__builtin_amdgcn_s_getreg((3 << 11) | 20) & 0xFu; }
#define XB_SPIN(cond, bar) do { unsigned _sp = 0; while (cond) { __builtin_amdgcn_s_sleep(1); \
    if ((++_sp & 255u) == 0u) { if (xb_ld(&(bar)[XB_TMO])) break; if (_sp > XB_SPIN_CAP) { atomicAdd(&(bar)[XB_TMO], 1u); break; } } } } while (0)

struct XcdBarrier {
    unsigned* bar; unsigned x;
    volatile LAS unsigned* st;
};

__device__ __forceinline__ XcdBarrier xcd_barrier_post(unsigned* bar, volatile LAS unsigned* st) {
    XcdBarrier b; b.bar = bar; b.x = xb_xcc_id(); b.st = st;
    if (threadIdx.x == 0) (void)xb_add(&bar[XB_XCNT(b.x)], 1u);
    return b;
}
__device__ __forceinline__ void xcd_barrier_complete(unsigned* bar, unsigned x, unsigned& nloc, unsigned& nx) {
    const unsigned G = gridDim.x * gridDim.y * gridDim.z;
    unsigned sum, cnt, mine, sp = 0u;
    for (;;) {
        sum = 0u; cnt = 0u; mine = 0u;
#pragma unroll
        for (unsigned j = 0; j < 16; ++j) { const unsigned c = xb_ld(&bar[XB_XCNT(j)]); sum += c; cnt += (c > 0u) ? 1u : 0u; mine = (j == x) ? c : mine; }
        if (sum == G) break;
        __builtin_amdgcn_s_sleep(1);
        if ((++sp & 255u) == 0u) { if (xb_ld(&bar[XB_TMO])) break; if (sp > XB_SPIN_CAP) { atomicAdd(&bar[XB_TMO], 1u); break; } }
    }
    nloc = mine > 0u ? mine : 1u; nx = cnt > 0u ? cnt : 1u;
}

__device__ __forceinline__ void xcd_barrier(const XcdBarrier& b) {
    asm volatile("s_waitcnt vmcnt(0)" ::: "memory");
    __syncthreads();
    if (threadIdx.x == 0) {
        unsigned* bar = b.bar;
        __builtin_amdgcn_s_waitcnt(0);
        unsigned nloc = b.st[0], nx = b.st[1];
        if (nloc == 0u) { xcd_barrier_complete(bar, b.x, nloc, nx); b.st[0] = nloc; b.st[1] = nx; }
        const unsigned old = xb_add(&bar[XB_XSUB(b.x)], 1u);
        const unsigned gen = old / nloc;
        if (old + 1u == (gen + 1u) * nloc) {
            __builtin_amdgcn_fence(__ATOMIC_RELEASE, "agent");
            asm volatile("s_waitcnt vmcnt(0)" ::: "memory");
            const unsigned og = xb_add(&bar[XB_TOP], 1u);
            const unsigned tg = og / nx;
            if (og + 1u == (tg + 1u) * nx) xb_add(&bar[XB_TOPGEN], 1u);
            else XB_SPIN(xb_ld(&bar[XB_TOPGEN]) == tg, bar);
            __builtin_amdgcn_fence(__ATOMIC_ACQUIRE, "agent");
            xb_add(&bar[XB_XGEN(b.x)], 1u);
            asm volatile("s_waitcnt vmcnt(0)" ::: "memory");
        } else {
            XB_SPIN(xb_ld(&bar[XB_XGEN(b.x)]) == gen, bar);
            __builtin_amdgcn_fence(__ATOMIC_ACQUIRE, "agent");
            asm volatile("s_waitcnt vmcnt(0)" ::: "memory");
        }
    }
    __syncthreads();
}

struct Params { const float* in[27]; float* out; unsigned char* ws; int ph_lo, ph_hi; };
enum { I_X = 0, I_WIN, I_GMNG, I_GMNB, I_GMWS, I_GMBS, I_CONVW, I_ALOG, I_DTB, I_GDNNG, I_MLIB, I_MLFB, I_MLNG, I_WBR, I_WOUT, I_LN1G, I_LN1B,
       I_WR, I_RB, I_WG, I_WU, I_WD, I_SG, I_SU, I_SD, I_LN2G, I_LN2B };

using pg8::f32x4; using pg8::u32x4; using pg8::Unit; using pg8::HALF; using pg8::BM;

struct EpiMergeH {
    static constexpr bool PERM = true, AFTER_DRAIN = false; static constexpr int MID = BW / pg8::BK;
    const bf16* Z; bf16* msum;
    __device__ __forceinline__ void mid(f32x4 (&acc)[2][2][4][2], const Unit& u, int j, int wr, int wc, int fr, int fq) const {
        int row0 = u.pm * BM + wr * 64 + fr; const int col0 = u.pn * BM + wc * 32 + 8 * fq; asm volatile("" : "+v"(row0));
        const bf16* zp = Z + ZC_GATE + (size_t)(j - 1) * D + col0;
#pragma unroll
        for (int am = 0; am < 4; ++am) { const int ai = am >> 1, m0 = (am & 1) * 2; v4u ga[2][2], gb[2][2];
#pragma unroll
            for (int m = 0; m < 2; ++m)
#pragma unroll
                for (int bj = 0; bj < 2; ++bj) { const bf16* q = zp + (size_t)(row0 + ai * HALF + (m0 + m) * 16) * ZC + bj * HALF; ga[m][bj] = *(const v4u*)q; gb[m][bj] = *(const v4u*)(q + D); }
#pragma unroll
            for (int m = 0; m < 2; ++m)
#pragma unroll
                for (int bj = 0; bj < 2; ++bj) { float a[8], b[8]; unpack8(ga[m][bj], a); unpack8(gb[m][bj], b);
#pragma unroll
                    for (int i = 0; i < 8; ++i) { const float ea = __builtin_amdgcn_exp2f(fmaxf(a[i], -60.f) * -1.44269504f), eb = __builtin_amdgcn_exp2f(fmaxf(b[i], -60.f) * -1.44269504f);
                        acc[ai][bj][m0 + m][i >> 2][i & 3] *= (1.f + eb) * __builtin_amdgcn_rcpf(1.f + ea); } }
            asm volatile("" ::: "memory"); }
    }
    __device__ __forceinline__ void operator()(const f32x4 (&acc)[2][2][4][2], const Unit& u, int wr, int wc, int fr, int fq) const {
        const int row0 = u.pm * BM + wr * 64 + fr, col0 = u.pn * BM + wc * 32 + 8 * fq;
#pragma unroll
        for (int ai = 0; ai < 2; ++ai) { v4u gg[4][2];
#pragma unroll
            for (int m = 0; m < 4; ++m)
#pragma unroll
                for (int bj = 0; bj < 2; ++bj) gg[m][bj] = *(const v4u*)(Z + (size_t)(row0 + ai * HALF + m * 16) * ZC + ZC_GATE + 3 * D + col0 + bj * HALF);
#pragma unroll
            for (int m = 0; m < 4; ++m)
#pragma unroll
                for (int bj = 0; bj < 2; ++bj) { const size_t row = (size_t)(row0 + ai * HALF + m * 16); const int col = col0 + bj * HALF; float gl[8]; unpack8(gg[m][bj], gl);
                    f32x4 v0 = acc[ai][bj][m][0], v1 = acc[ai][bj][m][1];
#pragma unroll
                    for (int j = 0; j < 4; ++j) { v0[j] *= sigmoidf_(gl[j]); v1[j] *= sigmoidf_(gl[4 + j]); }
                    unsigned w0 = 0, w1 = 0; w0 = __builtin_amdgcn_cvt_pk_fp8_f32(v0[0], v0[1], w0, false); w0 = __builtin_amdgcn_cvt_pk_fp8_f32(v0[2], v0[3], w0, true); w1 = __builtin_amdgcn_cvt_pk_fp8_f32(v1[0], v1[1], w1, false); w1 = __builtin_amdgcn_cvt_pk_fp8_f32(v1[2], v1[3], w1, true);
                    *(v2u*)((unsigned char*)msum + row * D + col) = (v2u){w0, w1}; }
            asm volatile("" ::: "memory"); }
    }
};
struct EpiResid {
    static constexpr bool PERM = false, AFTER_DRAIN = false; static constexpr int MID = 0;
    const float* X; float* Y; float sc;
    __device__ __forceinline__ void operator()(const f32x4 (&acc)[2][2][4][2], const Unit& u, int wr, int wc, int fr, int fq) const {
        const int row0 = u.pm * BM + wr * 64 + fr, col0 = u.pn * BM + wc * 32 + 4 * fq;
#pragma unroll
        for (int ai = 0; ai < 2; ++ai)
#pragma unroll
            for (int m = 0; m < 4; ++m) { const size_t off = (size_t)(row0 + ai * HALF + m * 16) * D + col0;
#pragma unroll
                for (int bj = 0; bj < 2; ++bj)
#pragma unroll
                    for (int n = 0; n < 2; ++n) { const f32x4 xv = *(const f32x4*)(X + off + bj * HALF + n * 16); *(f32x4*)(Y + off + bj * HALF + n * 16) = xv * ALPHA + acc[ai][bj][m][n] * sc; } }
    }
};
struct MoeTab {
    LAS int* t; LAS unsigned short* tok; LAS float* wt; LAS unsigned char* mte;
    __device__ __forceinline__ MoeTab(LAS unsigned char* lds) : t((LAS int*)(lds + TAB_OFF)), tok((LAS unsigned short*)(lds + TAB_OFF + 1024)), wt((LAS float*)(lds + TAB_OFF + 5120)), mte((LAS unsigned char*)(lds + TAB_OFF + 13312)) {}
};
__device__ __forceinline__ void moe_tables(const MoeTab& M, const unsigned* cnt  , int tid, int lane, int wave) {
    __syncthreads();
    if (wave == 0) { const int c = (int)cnt[64 * lane]; const int tiles = (c + 255) >> 8; const float incl = wave_scan_incl((float)tiles);
        M.t[80 + lane] = c; M.t[lane] = (int)incl - tiles; if (lane == 63) { M.t[64] = (int)incl; M.t[65] = (int)incl + T / 256; M.t[80 + 64] = T; } }
    __syncthreads();
    const int Mt = M.t[65];
    for (int mt = tid; mt < Mt; mt += 512) { int e = 0;
        for (int k = 1; k <= 64; ++k) e = (M.t[k] <= mt) ? k : e;
        M.mte[mt] = (unsigned char)e; }
    __syncthreads();
}
struct UpOrder {
    MoeTab M; int n;
    __device__ __forceinline__ bool next(int i, Unit& u) const { if (i >= n) return false; u.pm = M.t[168 + i]; u.pn = M.t[176 + i]; u.aux = i; return true; }
    __device__ __forceinline__ int row_token(int i, int r) const { return (int)M.tok[i * 256 + r]; }
    __device__ __forceinline__ void a_ready(const Unit&) const {}
    __device__ __forceinline__ void done(const Unit&) const {}
};
__device__ __forceinline__ int up_order_build(const MoeTab& M, const int* LIST, const float* WL, int wg, int G, int tid) {
    const int U = 4 * M.t[65];
    if (tid < 8) { const int L = tid * G + wg; if (L < U) { const int mt = L >> 2, q = L & 3, e = M.mte[mt]; M.t[168 + tid] = mt; M.t[176 + tid] = e * 4 + q; M.t[184 + tid] = e; M.t[192 + tid] = mt - M.t[e]; } }
    int n = 0;
#pragma unroll
    for (int i = 0; i < 8; ++i) n += (i * G + wg < U) ? 1 : 0;
    __syncthreads();
    for (int idx = tid; idx < n * 256; idx += 512) { const int i = idx >> 8, r = idx & 255, e = M.t[184 + i], li = M.t[192 + i] * 256 + r;
        int tk = 0; float w = 0.f;
        if (e < NE) { if (li < M.t[80 + e]) { tk = LIST[e * T + li]; w = WL[e * T + li]; } } else { tk = li; w = 1.f; }
        M.tok[idx] = (unsigned short)tk; M.wt[idx] = w; }
    __syncthreads();
    return n;
}
struct EpiGluSparse {
    static constexpr bool PERM = true, AFTER_DRAIN = false; static constexpr int MID = 0;
    LAS const float* wt; bf16* H;
    __device__ __forceinline__ void operator()(const f32x4 (&acc)[2][2][4][2], const Unit& u, int wr, int wc, int fr, int fq) const {
        const int q = u.pn & 3; const int rl0 = wr * 64 + fr, col0 = q * 128 + wc * 32 + 8 * fq;
#pragma unroll
        for (int ai = 0; ai < 2; ++ai)
#pragma unroll
            for (int m = 0; m < 4; ++m) { const int rl = rl0 + ai * HALF + m * 16; const float c = wt[u.aux * 256 + rl]; float h[8];
#pragma unroll
                for (int n = 0; n < 2; ++n)
#pragma unroll
                    for (int j = 0; j < 4; ++j) h[4 * n + j] = siluf_(acc[ai][0][m][n][j] * UPSC) * (acc[ai][1][m][n][j] * UPSC) * c;
                u32x4 w; w.x = pk2(h[0], h[1]); w.y = pk2(h[2], h[3]); w.z = pk2(h[4], h[5]); w.w = pk2(h[6], h[7]);
                *(u32x4*)(H + ((size_t)u.pm * 256 + rl) * ED + col0) = w; }
    }
};
struct DownOrder {
    MoeTab M; int G, c, U;
    __device__ __forceinline__ bool next(int i, Unit& u) const { const int L = i * G + c; if (L >= U) return false; const int mt = L >> 3; u.pm = mt; u.pn = (int)M.mte[mt] * 8 + (L & 7); u.aux = 0; return true; }
    __device__ __forceinline__ void a_ready(const Unit&) const {}
    __device__ __forceinline__ void done(const Unit&) const {}
};
struct EpiYexp {
    static constexpr bool PERM = true, AFTER_DRAIN = false; static constexpr int MID = 0;
    bf16* Y;
    __device__ __forceinline__ void operator()(const f32x4 (&acc)[2][2][4][2], const Unit& u, int wr, int wc, int fr, int fq) const {
        const int row0 = u.pm * BM + wr * 64 + fr, col0 = (u.pn & 7) * BM + wc * 32 + 8 * fq;
#pragma unroll
        for (int ai = 0; ai < 2; ++ai)
#pragma unroll
            for (int m = 0; m < 4; ++m) { bf16* rowp = Y + (size_t)(row0 + ai * HALF + m * 16) * D + col0;
#pragma unroll
                for (int bj = 0; bj < 2; ++bj) { const f32x4 v0 = acc[ai][bj][m][0], v1 = acc[ai][bj][m][1];
                    u32x4 w; w.x = pk2(v0[0], v0[1]); w.y = pk2(v0[2], v0[3]); w.z = pk2(v1[0], v1[1]); w.w = pk2(v1[2], v1[3]); *(u32x4*)(rowp + bj * HALF) = w; } }
    }
};

struct TrItem { const float* src; bf16* dst; unsigned sld, dld; int f8; };
__device__ __forceinline__ void tr_load(const TrItem& t, int lane, v4f (&v)[8]) { const int r8 = lane >> 3, c4 = lane & 7;
#pragma unroll
    for (int i = 0; i < 8; ++i) v[i] = *(const v4f*)(t.src + (size_t)(8 * i + r8) * t.sld + 4 * c4); }
__device__ __forceinline__ void tr_store(const TrItem& t, const v4f (&v)[8], LAS float* scr, int lane) {
    { const int r8 = lane >> 3, c4 = lane & 7;
#pragma unroll
      for (int i = 0; i < 8; ++i) { LAS float* d = scr + (8 * i + r8) * 33 + 4 * c4; d[0] = v[i].x; d[1] = v[i].y; d[2] = v[i].z; d[3] = v[i].w; } }
    LDS_WAIT(); asm volatile("" ::: "memory");
    if (t.f8) {
        const int c = lane & 3;
#pragma unroll
        for (int j = 0; j < 2; ++j) { const int n = (lane >> 2) + 16 * j; const LAS float* s = scr + (16 * c) * 33 + n; unsigned w[4];
#pragma unroll
            for (int q = 0; q < 4; ++q) { unsigned x = 0; x = __builtin_amdgcn_cvt_pk_fp8_f32(s[(4 * q) * 33] * 64.f, s[(4 * q + 1) * 33] * 64.f, x, false); x = __builtin_amdgcn_cvt_pk_fp8_f32(s[(4 * q + 2) * 33] * 64.f, s[(4 * q + 3) * 33] * 64.f, x, true); w[q] = x; }
            *(v4u*)((unsigned char*)t.dst + (size_t)n * t.dld + 16 * c) = (v4u){w[0], w[1], w[2], w[3]}; }
    } else {
        const int c = lane & 7;
#pragma unroll
        for (int j = 0; j < 4; ++j) { const int n = (lane >> 3) + 8 * j; const LAS float* s = scr + (8 * c) * 33 + n;
            v4u o; o.x = pk2(s[0 * 33], s[1 * 33]); o.y = pk2(s[2 * 33], s[3 * 33]); o.z = pk2(s[4 * 33], s[5 * 33]); o.w = pk2(s[6 * 33], s[7 * 33]);
            *(v4u*)(t.dst + (size_t)n * t.dld + 8 * c) = o; }
    }
    LDS_WAIT(); asm volatile("" ::: "memory");
}
template <int PART> __device__ __forceinline__ TrItem tr_decode(const Params& p, int l, int it) {
    unsigned char* ws = p.ws;
    constexpr int N_IN = (ZC / 32) * (D / 64), N_BR = 4 * (BW / 64) * (D / 32), N_OUT = (D / 64) * (D / 32), N_UP = NEX * 2 * (D / 64) * (ED / 32);
    int r = it; TrItem t; t.f8 = 0;
    if (PART == 0) {
        const float* w_in = p.in[I_WIN] + (size_t)l * D * INC; const float* w_br = p.in[I_WBR] + (size_t)l * 4 * BW * D; const float* w_out = p.in[I_WOUT] + (size_t)l * D * D;
        bf16* WIN = (bf16*)(ws + WS_WIN); bf16* WBR = (bf16*)(ws + WS_WBR); bf16* WOUT = (bf16*)(ws + WS_WOUT);
        if (r < N_IN) { const int kb = r / (ZC / 32), n0 = (r % (ZC / 32)) * 32, k0 = kb * 64; const int sc = n0 + (n0 >= ZC_GATE ? 16 : (n0 >= ZC_MLQ ? 8 : 0));
            t.src = w_in + (size_t)k0 * INC + sc; t.sld = INC; t.dst = (bf16*)((unsigned char*)WIN + (size_t)n0 * D + k0); t.dld = D; t.f8 = 1; return t; } r -= N_IN;
        if (r < N_BR) { const int g = r / 512, rr = r % 512, k0 = (rr / 64) * 64, n0 = (rr % 64) * 32;
            t.src = w_br + ((size_t)g * BW + k0) * D + n0; t.sld = D; t.dst = WBR + (size_t)n0 * BRW + g * BW + k0; t.dld = BRW; return t; } r -= N_BR;
        { const int k0 = (r / 64) * 64, n0 = (r % 64) * 32; t.src = w_out + (size_t)k0 * D + n0; t.sld = D; t.dst = (bf16*)((unsigned char*)WOUT + (size_t)n0 * D + k0); t.dld = D; t.f8 = 1; return t; }
    } else {
        const float* w_g = p.in[I_WG] + (size_t)l * NE * D * ED; const float* w_u = p.in[I_WU] + (size_t)l * NE * D * ED; const float* w_d = p.in[I_WD] + (size_t)l * NE * ED * D;
        const float* s_g = p.in[I_SG] + (size_t)l * D * ED; const float* s_u = p.in[I_SU] + (size_t)l * D * ED; const float* s_d = p.in[I_SD] + (size_t)l * ED * D;
        bf16* WUP = (bf16*)(ws + WS_WUP); bf16* WDN = (bf16*)(ws + WS_WDN);
        if (r < N_UP) { const int e = r / 1024, rr = r % 1024, mat = rr / 512, r2 = rr % 512, k0 = (r2 / 16) * 64, n0 = (r2 % 16) * 32;
            const float* sb = (e < NE) ? ((mat ? w_u : w_g) + (size_t)e * D * ED) : (mat ? s_u : s_g);
            const int drow = e * 1024 + (n0 / 128) * 256 + mat * 128 + (n0 % 128);
            t.src = sb + (size_t)k0 * ED + n0; t.sld = ED;
#if MOE_UP_FP8
            t.dst = (bf16*)((unsigned char*)WUP + (size_t)drow * D + k0); t.dld = D; t.f8 = 1; return t; }
#else
            t.dst = WUP + (size_t)drow * D + k0; t.dld = D; return t; }
#endif
        r -= N_UP;
        { const int e = r / 512, rr = r % 512, k0 = (rr / 64) * 64, n0 = (rr % 64) * 32;
            const float* sb = (e < NE) ? (w_d + (size_t)e * ED * D) : s_d;
            t.src = sb + (size_t)k0 * D + n0; t.sld = D; t.dst = WDN + ((size_t)e * D + n0) * ED + k0; t.dld = ED; return t; }
    }
}
template <int PART> __device__ __forceinline__ void phase_convert(const Params& p, int l, LAS unsigned char* lds, int gw, int NGW, int wave, int lane) {
    constexpr int N_IN = (ZC / 32) * (D / 64), N_BR = 4 * (BW / 64) * (D / 32), N_OUT = (D / 64) * (D / 32), N_UP = NEX * 2 * (D / 64) * (ED / 32), N_DN = NEX * (ED / 64) * (D / 32);
    constexpr int NITEMS = (PART == 0) ? (N_IN + N_BR + N_OUT) : (N_UP + N_DN);
    LAS float* scr = (LAS float*)(lds + wave * 16384);
    if (gw >= NITEMS) return;
    TrItem cur = tr_decode<PART>(p, l, gw); v4f va[8], vb[8];
    tr_load(cur, lane, va);
    for (int it = gw; it < NITEMS; it += 2 * NGW) {
        const int i1 = it + NGW, i2 = it + 2 * NGW; TrItem nx = cur;
        if (i1 < NITEMS) { nx = tr_decode<PART>(p, l, i1); } tr_load(nx, lane, vb);
        tr_store(cur, va, scr, lane);
        if (i1 >= NITEMS) break;
        cur = nx; if (i2 < NITEMS) { cur = tr_decode<PART>(p, l, i2); } tr_load(cur, lane, va);
        tr_store(nx, vb, scr, lane);
        if (i2 >= NITEMS) break;
    }
}
__device__ __forceinline__ void phase_xprep(const Params& p, int l, const float* xin, LAS unsigned char* lds, int gw, int NGW, int tid, int lane) {
    const float* w_in = p.in[I_WIN] + (size_t)l * D * INC; LAS float* wsm = (LAS float*)lds;
    __syncthreads();
    for (int idx = tid; idx < D * 16; idx += 512) { const int d = idx >> 4, c = idx & 15; wsm[c * D + d] = w_in[(size_t)d * INC + (c < 8 ? 4608 + c : 6152 + (c - 8))]; }
    __syncthreads();
    bf16* XB = (bf16*)(p.ws + WS_XB); float* SMALL = (float*)(p.ws + WS_SMALL);
    for (int m = gw; m < T; m += NGW) {
        const v4f* xr = (const v4f*)(xin + (size_t)m * D) + lane; v4f v[8];
#pragma unroll
        for (int j = 0; j < 8; ++j) v[j] = xr[64 * j];
        unsigned* xo = (unsigned*)((unsigned char*)XB + (size_t)m * D) + lane;
#pragma unroll
        for (int j = 0; j < 8; ++j) { unsigned w = 0; w = __builtin_amdgcn_cvt_pk_fp8_f32(v[j].x, v[j].y, w, false); w = __builtin_amdgcn_cvt_pk_fp8_f32(v[j].z, v[j].w, w, true); xo[64 * j] = w; }
        float res = 0.f;
#pragma unroll 1
        for (int c = 0; c < 16; ++c) { float a = 0.f;
#pragma unroll
            for (int j = 0; j < 8; ++j) { const v4f w = *(const LAS v4f*)(wsm + c * D + 4 * lane + 256 * j); a += v[j].x * w.x + v[j].y * w.y + v[j].z * w.z + v[j].w * w.w; }
            a = wave_sum(a); if (lane == c) res = a; }
        if (lane < 16) SMALL[(size_t)m * 16 + lane] = res;
    }
    __syncthreads();
}


typedef short bf16x8_t __attribute__((ext_vector_type(8)));
__device__ __forceinline__ void ml_pre_item(const Params& p, int l, LAS unsigned char* lds, int item, int tid, int wave, int lane) {
    const int h = item & 3, n = item >> 2; const size_t t0 = (size_t)n * 64;
    const bf16* Z = (const bf16*)(p.ws + WS_Z); const float* SMALL = (const float*)(p.ws + WS_SMALL);
    bf16* MQ = (bf16*)(p.ws + WS_MQ) + (size_t)item * 4096; bf16* MS = (bf16*)(p.ws + WS_MS) + (size_t)item * 4096; bf16* MK = (bf16*)(p.ws + WS_MK) + (size_t)item * 4096;
    bf16* MV = (bf16*)(p.ws + WS_MV) + (size_t)item * 9216; float* MFL = (float*)(p.ws + WS_MFL);
    LAS float* qs = (LAS float*)lds;
    LAS float* ks = qs + 64 * 65;
    LAS float* bs = ks + 64 * 65;
    LAS unsigned short* vs = (LAS unsigned short*)(bs + 128);
    { const int tk = tid >> 3, c8 = tid & 7; float f[8];
      unpack8(*(const v4u*)(Z + (t0 + tk) * ZC + ZC_MLQ + h * 64 + 8 * c8), f);
#pragma unroll
      for (int i = 0; i < 8; ++i) qs[tk * 65 + 8 * c8 + i] = f[i];
      unpack8(*(const v4u*)(Z + (t0 + tk) * ZC + ZC_MLK + h * 64 + 8 * c8), f);
#pragma unroll
      for (int i = 0; i < 8; ++i) ks[tk * 65 + 8 * c8 + i] = f[i]; }
#pragma unroll
    for (int r = 0; r < 2; ++r) { const int idx = tid + 512 * r, tk = idx >> 4, c8 = idx & 15;
        *(LAS v4u*)(vs + tk * 136 + 8 * c8) = *(const v4u*)(Z + (t0 + tk) * ZC + ZC_MLV + h * 128 + 8 * c8); }
    if (wave == 0) { const float fp = SMALL[(t0 + lane) * 16 + 12 + h] + p.in[I_MLFB][l * 4 + h]; const float lf = -softplusf_(-fp);
        bs[lane] = wave_scan_incl(lf); bs[64 + lane] = SMALL[(t0 + lane) * 16 + 8 + h] + p.in[I_MLIB][l * 4 + h]; }
    __syncthreads();
    const float blast = bs[63];
    { const int i = tid >> 3, jb = tid & 7; const float bi = bs[i];
      { const float e = __expf(bi) * 0.125f; float o[8];
#pragma unroll
        for (int x = 0; x < 8; ++x) o[x] = qs[i * 65 + 8 * jb + x] * e;
        v4u w; w.x = pk2(o[0], o[1]); w.y = pk2(o[2], o[3]); w.z = pk2(o[4], o[5]); w.w = pk2(o[6], o[7]); *(v4u*)(MQ + i * 64 + 8 * jb) = w; }
      { float d[8];
#pragma unroll
        for (int x = 0; x < 8; ++x) d[x] = 0.f;
        if (8 * jb <= i) {
            for (int dd = 0; dd < 64; ++dd) { const float qv = qs[i * 65 + dd];
#pragma unroll
                for (int x = 0; x < 8; ++x) d[x] += qv * ks[(8 * jb + x) * 65 + dd]; }
#pragma unroll
            for (int x = 0; x < 8; ++x) { const int j = 8 * jb + x; d[x] = (j <= i) ? __expf(bi - bs[j] + bs[64 + j]) * d[x] * 0.125f : 0.f; } }
        v4u w; w.x = pk2(d[0], d[1]); w.y = pk2(d[2], d[3]); w.z = pk2(d[4], d[5]); w.w = pk2(d[6], d[7]); *(v4u*)(MS + i * 64 + 8 * jb) = w; }
      { float o[8];
#pragma unroll
        for (int x = 0; x < 8; ++x) { const int j = 8 * jb + x; o[x] = ks[j * 65 + i] * __expf(blast - bs[j] + bs[64 + j]); }
        v4u w; w.x = pk2(o[0], o[1]); w.y = pk2(o[2], o[3]); w.z = pk2(o[4], o[5]); w.w = pk2(o[6], o[7]); *(v4u*)(MK + i * 64 + 8 * jb) = w; }
    }
    { const int c = tid >> 2, jq = tid & 3; unsigned w[8];
#pragma unroll
      for (int x = 0; x < 8; ++x) w[x] = (unsigned)vs[(16 * jq + 2 * x) * 136 + c] | ((unsigned)vs[(16 * jq + 2 * x + 1) * 136 + c] << 16);
      *(v4u*)(MV + c * 64 + 16 * jq) = (v4u){w[0], w[1], w[2], w[3]}; *(v4u*)(MV + c * 64 + 16 * jq + 8) = (v4u){w[4], w[5], w[6], w[7]};
      if (tid < 64) { const int c2 = 128 + (tid >> 2); const unsigned one = (c2 == 128) ? 0x3F803F80u : 0u;
          *(v4u*)(MV + c2 * 64 + 16 * jq) = (v4u){one, one, one, one}; *(v4u*)(MV + c2 * 64 + 16 * jq + 8) = (v4u){one, one, one, one}; } }
    if (tid == 0) MFL[item] = __expf(blast);
    __syncthreads();
}
struct MlFrags { bf16x8_t q[2], s[2], kt[2], vt[2]; float fl; };
__device__ __forceinline__ void ml_load(MlFrags& F, const Params& p, int item, int offA, int offV) {
    const bf16* MQ = (const bf16*)(p.ws + WS_MQ) + (size_t)item * 4096; const bf16* MS = (const bf16*)(p.ws + WS_MS) + (size_t)item * 4096; const bf16* MK = (const bf16*)(p.ws + WS_MK) + (size_t)item * 4096;
    const bf16* MV = (const bf16*)(p.ws + WS_MV) + (size_t)item * 9216;
#pragma unroll
    for (int ks = 0; ks < 2; ++ks) { F.q[ks] = *(const bf16x8_t*)(MQ + offA + 32 * ks); F.s[ks] = *(const bf16x8_t*)(MS + offA + 32 * ks); F.kt[ks] = *(const bf16x8_t*)(MK + offA + 32 * ks); F.vt[ks] = *(const bf16x8_t*)(MV + offV + 32 * ks); }
    F.fl = ((const float*)(p.ws + WS_MFL))[item];
}
__device__ __forceinline__ void ml_seq(const Params& p, LAS unsigned char* lds, int wgi, int wave, int lane) {
    const int u = wgi * 2 + (wave >> 2), wi = wave & 3, h = u / 9, sl = u % 9, g = lane >> 4, c = lane & 15;
    LAS unsigned short* CT = (LAS unsigned short*)(lds + (wave >> 2) * 4096);
    float* HO = (float*)(p.ws + WS_HO); float* HDEN = (float*)(p.ws + WS_HDEN);
    const int offA = (16 * wi + c) * 64 + 8 * g, offV = (16 * sl + c) * 64 + 8 * g;
    *(LAS v2u*)(CT + c * 64 + 16 * wi + 4 * g) = (v2u){0u, 0u};
    pg8::f32x4 Cacc = {0.f, 0.f, 0.f, 0.f};
    __syncthreads();
    MlFrags F0, F1;
    ml_load(F0, p, h, offA, offV);
#define ML_STEP(F, n_) do { const int cur = (n_) & 1; \
        const bf16x8_t c0 = *(const LAS bf16x8_t*)(CT + cur * 1024 + c * 64 + 8 * g), c1 = *(const LAS bf16x8_t*)(CT + cur * 1024 + c * 64 + 32 + 8 * g); \
        pg8::f32x4 num = {0.f, 0.f, 0.f, 0.f}; \
        num = __builtin_amdgcn_mfma_f32_16x16x32_bf16(F.q[0], c0, num, 0, 0, 0); num = __builtin_amdgcn_mfma_f32_16x16x32_bf16(F.q[1], c1, num, 0, 0, 0); \
        num = __builtin_amdgcn_mfma_f32_16x16x32_bf16(F.s[0], F.vt[0], num, 0, 0, 0); num = __builtin_amdgcn_mfma_f32_16x16x32_bf16(F.s[1], F.vt[1], num, 0, 0, 0); \
        Cacc = Cacc * F.fl; \
        Cacc = __builtin_amdgcn_mfma_f32_16x16x32_bf16(F.kt[0], F.vt[0], Cacc, 0, 0, 0); Cacc = __builtin_amdgcn_mfma_f32_16x16x32_bf16(F.kt[1], F.vt[1], Cacc, 0, 0, 0); \
        { v2u w; w.x = pk2(Cacc[0], Cacc[1]); w.y = pk2(Cacc[2], Cacc[3]); *(LAS v2u*)(CT + (cur ^ 1) * 1024 + c * 64 + 16 * wi + 4 * g) = w; } \
        { const size_t tb = (size_t)(n_) * 64 + 16 * wi + 4 * g; \
          if (sl < 8) { _Pragma("unroll") for (int r = 0; r < 4; ++r) HO[(tb + r) * BW + h * 128 + 16 * sl + c] = num[r]; } \
          else if (c == 0) { _Pragma("unroll") for (int r = 0; r < 4; ++r) HDEN[(tb + r) * 4 + h] = num[r]; } } \
        LDS_BAR(); } while (0)
    for (int n = 0; n < T / 64; n += 2) {
        ml_load(F1, p, (n + 1) * 4 + h, offA, offV);
        ML_STEP(F0, n);
        ml_load(F0, p, ((n + 2 < T / 64) ? n + 2 : n) * 4 + h, offA, offV);
        ML_STEP(F1, n + 1);
    }
#undef ML_STEP
}


constexpr int QP = 132;
__device__ __forceinline__ void gdn_pre_item(const Params& p, int l, LAS unsigned char* lds, int item, int tid, int wave, int lane) {
    const int h = item & 3, n = item >> 2; const size_t t0 = (size_t)n * 64;
    const bf16* Z = (const bf16*)(p.ws + WS_Z); const float* SMALL = (const float*)(p.ws + WS_SMALL);
    float* GU = (float*)(p.ws + WS_GU) + (size_t)item * 8192; bf16* GNW = (bf16*)(p.ws + WS_GNW) + (size_t)item * 8192; bf16* GQG = (bf16*)(p.ws + WS_GQG) + (size_t)item * 8192;
    bf16* GAT = (bf16*)(p.ws + WS_GAT) + (size_t)item * 4096; bf16* GKT = (bf16*)(p.ws + WS_GKT) + (size_t)item * 8192; float* GDL = (float*)(p.ws + WS_GDL);
    const float* cw = p.in[I_CONVW] + (size_t)l * 4 * 1536;
    LAS float* qs = (LAS float*)lds; LAS float* ks = qs + 64 * QP; LAS float* vs = ks + 64 * QP; LAS float* Ls = vs + 64 * QP;   LAS float* gcs = Ls + 64 * 68; LAS float* bts = gcs + 64; LAS float* btg = bts + 64;
    { const int tk = tid >> 3, part = tid & 7;
#pragma unroll 1
      for (int i = 0; i < 3; ++i) { float a[16];
#pragma unroll
        for (int x = 0; x < 16; ++x) a[x] = 0.f;
#pragma unroll
        for (int j = 0; j < 4; ++j) { const long tt = (long)t0 + tk - 3 + j; if (tt >= 0) {
            const bf16* src = Z + (size_t)tt * ZC + ZC_GDN + i * 512 + h * 128 + 16 * part; float x0[8], x1[8]; unpack8(*(const v4u*)src, x0); unpack8(*(const v4u*)(src + 8), x1);
            const float* wp = cw + j * 1536 + i * 512 + h * 128 + 16 * part;
#pragma unroll
            for (int x = 0; x < 8; ++x) { a[x] += wp[x] * x0[x]; a[8 + x] += wp[8 + x] * x1[x]; } } }
        float ss = 0.f;
#pragma unroll
        for (int x = 0; x < 16; ++x) { a[x] = siluf_(a[x]); ss += a[x] * a[x]; }
        if (i < 2) { ss = sum8(ss); const float r = rsqrtf(ss + 1e-6f) * (i == 0 ? 0.08838834764831845f : 1.f);
#pragma unroll
            for (int x = 0; x < 16; ++x) a[x] *= r; }
        LAS float* dst = (i == 0 ? qs : (i == 1 ? ks : vs)) + tk * QP + 16 * part;
#pragma unroll
        for (int x4 = 0; x4 < 4; ++x4) *(LAS v4f*)(dst + 4 * x4) = (v4f){a[4 * x4], a[4 * x4 + 1], a[4 * x4 + 2], a[4 * x4 + 3]}; } }
    if (wave == 0) { const float bb = SMALL[(t0 + lane) * 16 + h], aa = SMALL[(t0 + lane) * 16 + 4 + h];
        const float g = -__expf(p.in[I_ALOG][l * 4 + h]) * softplusf_(aa + p.in[I_DTB][l * 4 + h]);
        const float gc = wave_scan_incl(g), bt = sigmoidf_(bb); gcs[lane] = gc; bts[lane] = bt; btg[lane] = bt * __expf(gc); }
    __syncthreads();
    { const int i = tid >> 3, jb = tid & 7; const float gi = gcs[i], bi = bts[i]; float dk[8], dq[8];
#pragma unroll
      for (int x = 0; x < 8; ++x) { dk[x] = 0.f; dq[x] = 0.f; }
      if (8 * jb <= i) {
#pragma unroll 2
          for (int d4 = 0; d4 < 32; ++d4) { const v4f qi = *(const LAS v4f*)(qs + i * QP + 4 * d4), ki = *(const LAS v4f*)(ks + i * QP + 4 * d4);
#pragma unroll
              for (int x = 0; x < 8; ++x) { const v4f kj = *(const LAS v4f*)(ks + (8 * jb + x) * QP + 4 * d4);
                  dk[x] += ki.x * kj.x + ki.y * kj.y + ki.z * kj.z + ki.w * kj.w; dq[x] += qi.x * kj.x + qi.y * kj.y + qi.z * kj.z + qi.w * kj.w; } }
#pragma unroll
          for (int x = 0; x < 8; ++x) { const int j = 8 * jb + x; const float dc = __expf(gi - gcs[j]); dk[x] = (j < i) ? bi * dk[x] * dc : 0.f; dq[x] = (j <= i) ? dq[x] * dc : 0.f; } }
      *(LAS v4f*)(Ls + i * 68 + 8 * jb) = (v4f){dk[0], dk[1], dk[2], dk[3]}; *(LAS v4f*)(Ls + i * 68 + 8 * jb + 4) = (v4f){dk[4], dk[5], dk[6], dk[7]};
      v4u w; w.x = pk2(dq[0], dq[1]); w.y = pk2(dq[2], dq[3]); w.z = pk2(dq[4], dq[5]); w.w = pk2(dq[6], dq[7]); *(v4u*)(GAT + i * 64 + 8 * jb) = w; }
    __syncthreads();
    if (tid < 256) {
        const int c = tid; int vz; asm volatile("v_mov_b32 %0, 0" : "=v"(vz));
        const LAS float* rp = (c < 128) ? (vs + c) : (ks + (c - 128)); const LAS float* mp = ((c < 128) ? bts : btg) + vz;
#define GDN_RHS(i) (rp[(i) * QP] * mp[(i)])
#define GDN_L4(i, j4) (*(const LAS v4f*)(Ls + (i) * 68 + 4 * (j4) + vz))
        float x0 = GDN_RHS(0); __builtin_amdgcn_sched_barrier(0);
        float x1 = GDN_RHS(1); { const v4f l = GDN_L4(1, 0); x1 -= l.x * x0; } __builtin_amdgcn_sched_barrier(0);
        float x2 = GDN_RHS(2); { const v4f l = GDN_L4(2, 0); x2 -= l.x * x0; x2 -= l.y * x1; } __builtin_amdgcn_sched_barrier(0);
        float x3 = GDN_RHS(3); { const v4f l = GDN_L4(3, 0); x3 -= l.x * x0; x3 -= l.y * x1; x3 -= l.z * x2; } __builtin_amdgcn_sched_barrier(0);
        float x4 = GDN_RHS(4); { const v4f l = GDN_L4(4, 0); x4 -= l.x * x0; x4 -= l.y * x1; x4 -= l.z * x2; x4 -= l.w * x3; } __builtin_amdgcn_sched_barrier(0);
        float x5 = GDN_RHS(5); { const v4f l = GDN_L4(5, 0); x5 -= l.x * x0; x5 -= l.y * x1; x5 -= l.z * x2; x5 -= l.w * x3; } { const v4f l = GDN_L4(5, 1); x5 -= l.x * x4; } __builtin_amdgcn_sched_barrier(0);
        float x6 = GDN_RHS(6); { const v4f l = GDN_L4(6, 0); x6 -= l.x * x0; x6 -= l.y * x1; x6 -= l.z * x2; x6 -= l.w * x3; } { const v4f l = GDN_L4(6, 1); x6 -= l.x * x4; x6 -= l.y * x5; } __builtin_amdgcn_sched_barrier(0);
        float x7 = GDN_RHS(7); { const v4f l = GDN_L4(7, 0); x7 -= l.x * x0; x7 -= l.y * x1; x7 -= l.z * x2; x7 -= l.w * x3; } { const v4f l = GDN_L4(7, 1); x7 -= l.x * x4; x7 -= l.y * x5; x7 -= l.z * x6; } __builtin_amdgcn_sched_barrier(0);
        float x8 = GDN_RHS(8); { const v4f l = GDN_L4(8, 0); x8 -= l.x * x0; x8 -= l.y * x1; x8 -= l.z * x2; x8 -= l.w * x3; } { const v4f l = GDN_L4(8, 1); x8 -= l.x * x4; x8 -= l.y * x5; x8 -= l.z * x6; x8 -= l.w * x7; } __builtin_amdgcn_sched_barrier(0);
        float x9 = GDN_RHS(9); { const v4f l = GDN_L4(9, 0); x9 -= l.x * x0; x9 -= l.y * x1; x9 -= l.z * x2; x9 -= l.w * x3; } { const v4f l = GDN_L4(9, 1); x9 -= l.x * x4; x9 -= l.y * x5; x9 -= l.z * x6; x9 -= l.w * x7; } { const v4f l = GDN_L4(9, 2); x9 -= l.x * x8; } __builtin_amdgcn_sched_barrier(0);
        float x10 = GDN_RHS(10); { const v4f l = GDN_L4(10, 0); x10 -= l.x * x0; x10 -= l.y * x1; x10 -= l.z * x2; x10 -= l.w * x3; } { const v4f l = GDN_L4(10, 1); x10 -= l.x * x4; x10 -= l.y * x5; x10 -= l.z * x6; x10 -= l.w * x7; } { const v4f l = GDN_L4(10, 2); x10 -= l.x * x8; x10 -= l.y * x9; } __builtin_amdgcn_sched_barrier(0);
        float x11 = GDN_RHS(11); { const v4f l = GDN_L4(11, 0); x11 -= l.x * x0; x11 -= l.y * x1; x11 -= l.z * x2; x11 -= l.w * x3; } { const v4f l = GDN_L4(11, 1); x11 -= l.x * x4; x11 -= l.y * x5; x11 -= l.z * x6; x11 -= l.w * x7; } { const v4f l = GDN_L4(11, 2); x11 -= l.x * x8; x11 -= l.y * x9; x11 -= l.z * x10; } __builtin_amdgcn_sched_barrier(0);
        float x12 = GDN_RHS(12); { const v4f l = GDN_L4(12, 0); x12 -= l.x * x0; x12 -= l.y * x1; x12 -= l.z * x2; x12 -= l.w * x3; } { const v4f l = GDN_L4(12, 1); x12 -= l.x * x4; x12 -= l.y * x5; x12 -= l.z * x6; x12 -= l.w * x7; } { const v4f l = GDN_L4(12, 2); x12 -= l.x * x8; x12 -= l.y * x9; x12 -= l.z * x10; x12 -= l.w * x11; } __builtin_amdgcn_sched_barrier(0);
        float x13 = GDN_RHS(13); { const v4f l = GDN_L4(13, 0); x13 -= l.x * x0; x13 -= l.y * x1; x13 -= l.z * x2; x13 -= l.w * x3; } { const v4f l = GDN_L4(13, 1); x13 -= l.x * x4; x13 -= l.y * x5; x13 -= l.z * x6; x13 -= l.w * x7; } { const v4f l = GDN_L4(13, 2); x13 -= l.x * x8; x13 -= l.y * x9; x13 -= l.z * x10; x13 -= l.w * x11; } { const v4f l = GDN_L4(13, 3); x13 -= l.x * x12; } __builtin_amdgcn_sched_barrier(0);
        float x14 = GDN_RHS(14); { const v4f l = GDN_L4(14, 0); x14 -= l.x * x0; x14 -= l.y * x1; x14 -= l.z * x2; x14 -= l.w * x3; } { const v4f l = GDN_L4(14, 1); x14 -= l.x * x4; x14 -= l.y * x5; x14 -= l.z * x6; x14 -= l.w * x7; } { const v4f l = GDN_L4(14, 2); x14 -= l.x * x8; x14 -= l.y * x9; x14 -= l.z * x10; x14 -= l.w * x11; } { const v4f l = GDN_L4(14, 3); x14 -= l.x * x12; x14 -= l.y * x13; } __builtin_amdgcn_sched_barrier(0);
        float x15 = GDN_RHS(15); { const v4f l = GDN_L4(15, 0); x15 -= l.x * x0; x15 -= l.y * x1; x15 -= l.z * x2; x15 -= l.w * x3; } { const v4f l = GDN_L4(15, 1); x15 -= l.x * x4; x15 -= l.y * x5; x15 -= l.z * x6; x15 -= l.w * x7; } { const v4f l = GDN_L4(15, 2); x15 -= l.x * x8; x15 -= l.y * x9; x15 -= l.z * x10; x15 -= l.w * x11; } { const v4f l = GDN_L4(15, 3); x15 -= l.x * x12; x15 -= l.y * x13; x15 -= l.z * x14; } __builtin_amdgcn_sched_barrier(0);
        float x16 = GDN_RHS(16); { const v4f l = GDN_L4(16, 0); x16 -= l.x * x0; x16 -= l.y * x1; x16 -= l.z * x2; x16 -= l.w * x3; } { const v4f l = GDN_L4(16, 1); x16 -= l.x * x4; x16 -= l.y * x5; x16 -= l.z * x6; x16 -= l.w * x7; } { const v4f l = GDN_L4(16, 2); x16 -= l.x * x8; x16 -= l.y * x9; x16 -= l.z * x10; x16 -= l.w * x11; } { const v4f l = GDN_L4(16, 3); x16 -= l.x * x12; x16 -= l.y * x13; x16 -= l.z * x14; x16 -= l.w * x15; } __builtin_amdgcn_sched_barrier(0);
        float x17 = GDN_RHS(17); { const v4f l = GDN_L4(17, 0); x17 -= l.x * x0; x17 -= l.y * x1; x17 -= l.z * x2; x17 -= l.w * x3; } { const v4f l = GDN_L4(17, 1); x17 -= l.x * x4; x17 -= l.y * x5; x17 -= l.z * x6; x17 -= l.w * x7; } { const v4f l = GDN_L4(17, 2); x17 -= l.x * x8; x17 -= l.y * x9; x17 -= l.z * x10; x17 -= l.w * x11; } { const v4f l = GDN_L4(17, 3); x17 -= l.x * x12; x17 -= l.y * x13; x17 -= l.z * x14; x17 -= l.w * x15; } { const v4f l = GDN_L4(17, 4); x17 -= l.x * x16; } __builtin_amdgcn_sched_barrier(0);
        float x18 = GDN_RHS(18); { const v4f l = GDN_L4(18, 0); x18 -= l.x * x0; x18 -= l.y * x1; x18 -= l.z * x2; x18 -= l.w * x3; } { const v4f l = GDN_L4(18, 1); x18 -= l.x * x4; x18 -= l.y * x5; x18 -= l.z * x6; x18 -= l.w * x7; } { const v4f l = GDN_L4(18, 2); x18 -= l.x * x8; x18 -= l.y * x9; x18 -= l.z * x10; x18 -= l.w * x11; } { const v4f l = GDN_L4(18, 3); x18 -= l.x * x12; x18 -= l.y * x13; x18 -= l.z * x14; x18 -= l.w * x15; } { const v4f l = GDN_L4(18, 4); x18 -= l.x * x16; x18 -= l.y * x17; } __builtin_amdgcn_sched_barrier(0);
        float x19 = GDN_RHS(19); { const v4f l = GDN_L4(19, 0); x19 -= l.x * x0; x19 -= l.y * x1; x19 -= l.z * x2; x19 -= l.w * x3; } { const v4f l = GDN_L4(19, 1); x19 -= l.x * x4; x19 -= l.y * x5; x19 -= l.z * x6; x19 -= l.w * x7; } { const v4f l = GDN_L4(19, 2); x19 -= l.x * x8; x19 -= l.y * x9; x19 -= l.z * x10; x19 -= l.w * x11; } { const v4f l = GDN_L4(19, 3); x19 -= l.x * x12; x19 -= l.y * x13; x19 -= l.z * x14; x19 -= l.w * x15; } { const v4f l = GDN_L4(19, 4); x19 -= l.x * x16; x19 -= l.y * x17; x19 -= l.z * x18; } __builtin_amdgcn_sched_barrier(0);
        float x20 = GDN_RHS(20); { const v4f l = GDN_L4(20, 0); x20 -= l.x * x0; x20 -= l.y * x1; x20 -= l.z * x2; x20 -= l.w * x3; } { const v4f l = GDN_L4(20, 1); x20 -= l.x * x4; x20 -= l.y * x5; x20 -= l.z * x6; x20 -= l.w * x7; } { const v4f l = GDN_L4(20, 2); x20 -= l.x * x8; x20 -= l.y * x9; x20 -= l.z * x10; x20 -= l.w * x11; } { const v4f l = GDN_L4(20, 3); x20 -= l.x * x12; x20 -= l.y * x13; x20 -= l.z * x14; x20 -= l.w * x15; } { const v4f l = GDN_L4(20, 4); x20 -= l.x * x16; x20 -= l.y * x17; x20 -= l.z * x18; x20 -= l.w * x19; } __builtin_amdgcn_sched_barrier(0);
        float x21 = GDN_RHS(21); { const v4f l = GDN_L4(21, 0); x21 -= l.x * x0; x21 -= l.y * x1; x21 -= l.z * x2; x21 -= l.w * x3; } { const v4f l = GDN_L4(21, 1); x21 -= l.x * x4; x21 -= l.y * x5; x21 -= l.z * x6; x21 -= l.w * x7; } { const v4f l = GDN_L4(21, 2); x21 -= l.x * x8; x21 -= l.y * x9; x21 -= l.z * x10; x21 -= l.w * x11; } { const v4f l = GDN_L4(21, 3); x21 -= l.x * x12; x21 -= l.y * x13; x21 -= l.z * x14; x21 -= l.w * x15; } { const v4f l = GDN_L4(21, 4); x21 -= l.x * x16; x21 -= l.y * x17; x21 -= l.z * x18; x21 -= l.w * x19; } { const v4f l = GDN_L4(21, 5); x21 -= l.x * x20; } __builtin_amdgcn_sched_barrier(0);
        float x22 = GDN_RHS(22); { const v4f l = GDN_L4(22, 0); x22 -= l.x * x0; x22 -= l.y * x1; x22 -= l.z * x2; x22 -= l.w * x3; } { const v4f l = GDN_L4(22, 1); x22 -= l.x * x4; x22 -= l.y * x5; x22 -= l.z * x6; x22 -= l.w * x7; } { const v4f l = GDN_L4(22, 2); x22 -= l.x * x8; x22 -= l.y * x9; x22 -= l.z * x10; x22 -= l.w * x11; } { const v4f l = GDN_L4(22, 3); x22 -= l.x * x12; x22 -= l.y * x13; x22 -= l.z * x14; x22 -= l.w * x15; } { const v4f l = GDN_L4(22, 4); x22 -= l.x * x16; x22 -= l.y * x17; x22 -= l.z * x18; x22 -= l.w * x19; } { const v4f l = GDN_L4(22, 5); x22 -= l.x * x20; x22 -= l.y * x21; } __builtin_amdgcn_sched_barrier(0);
        float x23 = GDN_RHS(23); { const v4f l = GDN_L4(23, 0); x23 -= l.x * x0; x23 -= l.y * x1; x23 -= l.z * x2; x23 -= l.w * x3; } { const v4f l = GDN_L4(23, 1); x23 -= l.x * x4; x23 -= l.y * x5; x23 -= l.z * x6; x23 -= l.w * x7; } { const v4f l = GDN_L4(23, 2); x23 -= l.x * x8; x23 -= l.y * x9; x23 -= l.z * x10; x23 -= l.w * x11; } { const v4f l = GDN_L4(23, 3); x23 -= l.x * x12; x23 -= l.y * x13; x23 -= l.z * x14; x23 -= l.w * x15; } { const v4f l = GDN_L4(23, 4); x23 -= l.x * x16; x23 -= l.y * x17; x23 -= l.z * x18; x23 -= l.w * x19; } { const v4f l = GDN_L4(23, 5); x23 -= l.x * x20; x23 -= l.y * x21; x23 -= l.z * x22; } __builtin_amdgcn_sched_barrier(0);
        float x24 = GDN_RHS(24); { const v4f l = GDN_L4(24, 0); x24 -= l.x * x0; x24 -= l.y * x1; x24 -= l.z * x2; x24 -= l.w * x3; } { const v4f l = GDN_L4(24, 1); x24 -= l.x * x4; x24 -= l.y * x5; x24 -= l.z * x6; x24 -= l.w * x7; } { const v4f l = GDN_L4(24, 2); x24 -= l.x * x8; x24 -= l.y * x9; x24 -= l.z * x10; x24 -= l.w * x11; } { const v4f l = GDN_L4(24, 3); x24 -= l.x * x12; x24 -= l.y * x13; x24 -= l.z * x14; x24 -= l.w * x15; } { const v4f l = GDN_L4(24, 4); x24 -= l.x * x16; x24 -= l.y * x17; x24 -= l.z * x18; x24 -= l.w * x19; } { const v4f l = GDN_L4(24, 5); x24 -= l.x * x20; x24 -= l.y * x21; x24 -= l.z * x22; x24 -= l.w * x23; } __builtin_amdgcn_sched_barrier(0);
        float x25 = GDN_RHS(25); { const v4f l = GDN_L4(25, 0); x25 -= l.x * x0; x25 -= l.y * x1; x25 -= l.z * x2; x25 -= l.w * x3; } { const v4f l = GDN_L4(25, 1); x25 -= l.x * x4; x25 -= l.y * x5; x25 -= l.z * x6; x25 -= l.w * x7; } { const v4f l = GDN_L4(25, 2); x25 -= l.x * x8; x25 -= l.y * x9; x25 -= l.z * x10; x25 -= l.w * x11; } { const v4f l = GDN_L4(25, 3); x25 -= l.x * x12; x25 -= l.y * x13; x25 -= l.z * x14; x25 -= l.w * x15; } { const v4f l = GDN_L4(25, 4); x25 -= l.x * x16; x25 -= l.y * x17; x25 -= l.z * x18; x25 -= l.w * x19; } { const v4f l = GDN_L4(25, 5); x25 -= l.x * x20; x25 -= l.y * x21; x25 -= l.z * x22; x25 -= l.w * x23; } { const v4f l = GDN_L4(25, 6); x25 -= l.x * x24; } __builtin_amdgcn_sched_barrier(0);
        float x26 = GDN_RHS(26); { const v4f l = GDN_L4(26, 0); x26 -= l.x * x0; x26 -= l.y * x1; x26 -= l.z * x2; x26 -= l.w * x3; } { const v4f l = GDN_L4(26, 1); x26 -= l.x * x4; x26 -= l.y * x5; x26 -= l.z * x6; x26 -= l.w * x7; } { const v4f l = GDN_L4(26, 2); x26 -= l.x * x8; x26 -= l.y * x9; x26 -= l.z * x10; x26 -= l.w * x11; } { const v4f l = GDN_L4(26, 3); x26 -= l.x * x12; x26 -= l.y * x13; x26 -= l.z * x14; x26 -= l.w * x15; } { const v4f l = GDN_L4(26, 4); x26 -= l.x * x16; x26 -= l.y * x17; x26 -= l.z * x18; x26 -= l.w * x19; } { const v4f l = GDN_L4(26, 5); x26 -= l.x * x20; x26 -= l.y * x21; x26 -= l.z * x22; x26 -= l.w * x23; } { const v4f l = GDN_L4(26, 6); x26 -= l.x * x24; x26 -= l.y * x25; } __builtin_amdgcn_sched_barrier(0);
        float x27 = GDN_RHS(27); { const v4f l = GDN_L4(27, 0); x27 -= l.x * x0; x27 -= l.y * x1; x27 -= l.z * x2; x27 -= l.w * x3; } { const v4f l = GDN_L4(27, 1); x27 -= l.x * x4; x27 -= l.y * x5; x27 -= l.z * x6; x27 -= l.w * x7; } { const v4f l = GDN_L4(27, 2); x27 -= l.x * x8; x27 -= l.y * x9; x27 -= l.z * x10; x27 -= l.w * x11; } { const v4f l = GDN_L4(27, 3); x27 -= l.x * x12; x27 -= l.y * x13; x27 -= l.z * x14; x27 -= l.w * x15; } { const v4f l = GDN_L4(27, 4); x27 -= l.x * x16; x27 -= l.y * x17; x27 -= l.z * x18; x27 -= l.w * x19; } { const v4f l = GDN_L4(27, 5); x27 -= l.x * x20; x27 -= l.y * x21; x27 -= l.z * x22; x27 -= l.w * x23; } { const v4f l = GDN_L4(27, 6); x27 -= l.x * x24; x27 -= l.y * x25; x27 -= l.z * x26; } __builtin_amdgcn_sched_barrier(0);
        float x28 = GDN_RHS(28); { const v4f l = GDN_L4(28, 0); x28 -= l.x * x0; x28 -= l.y * x1; x28 -= l.z * x2; x28 -= l.w * x3; } { const v4f l = GDN_L4(28, 1); x28 -= l.x * x4; x28 -= l.y * x5; x28 -= l.z * x6; x28 -= l.w * x7; } { const v4f l = GDN_L4(28, 2); x28 -= l.x * x8; x28 -= l.y * x9; x28 -= l.z * x10; x28 -= l.w * x11; } { const v4f l = GDN_L4(28, 3); x28 -= l.x * x12; x28 -= l.y * x13; x28 -= l.z * x14; x28 -= l.w * x15; } { const v4f l = GDN_L4(28, 4); x28 -= l.x * x16; x28 -= l.y * x17; x28 -= l.z * x18; x28 -= l.w * x19; } { const v4f l = GDN_L4(28, 5); x28 -= l.x * x20; x28 -= l.y * x21; x28 -= l.z * x22; x28 -= l.w * x23; } { const v4f l = GDN_L4(28, 6); x28 -= l.x * x24; x28 -= l.y * x25; x28 -= l.z * x26; x28 -= l.w * x27; } __builtin_amdgcn_sched_barrier(0);
        float x29 = GDN_RHS(29); { const v4f l = GDN_L4(29, 0); x29 -= l.x * x0; x29 -= l.y * x1; x29 -= l.z * x2; x29 -= l.w * x3; } { const v4f l = GDN_L4(29, 1); x29 -= l.x * x4; x29 -= l.y * x5; x29 -= l.z * x6; x29 -= l.w * x7; } { const v4f l = GDN_L4(29, 2); x29 -= l.x * x8; x29 -= l.y * x9; x29 -= l.z * x10; x29 -= l.w * x11; } { const v4f l = GDN_L4(29, 3); x29 -= l.x * x12; x29 -= l.y * x13; x29 -= l.z * x14; x29 -= l.w * x15; } { const v4f l = GDN_L4(29, 4); x29 -= l.x * x16; x29 -= l.y * x17; x29 -= l.z * x18; x29 -= l.w * x19; } { const v4f l = GDN_L4(29, 5); x29 -= l.x * x20; x29 -= l.y * x21; x29 -= l.z * x22; x29 -= l.w * x23; } { const v4f l = GDN_L4(29, 6); x29 -= l.x * x24; x29 -= l.y * x25; x29 -= l.z * x26; x29 -= l.w * x27; } { const v4f l = GDN_L4(29, 7); x29 -= l.x * x28; } __builtin_amdgcn_sched_barrier(0);
        float x30 = GDN_RHS(30); { const v4f l = GDN_L4(30, 0); x30 -= l.x * x0; x30 -= l.y * x1; x30 -= l.z * x2; x30 -= l.w * x3; } { const v4f l = GDN_L4(30, 1); x30 -= l.x * x4; x30 -= l.y * x5; x30 -= l.z * x6; x30 -= l.w * x7; } { const v4f l = GDN_L4(30, 2); x30 -= l.x * x8; x30 -= l.y * x9; x30 -= l.z * x10; x30 -= l.w * x11; } { const v4f l = GDN_L4(30, 3); x30 -= l.x * x12; x30 -= l.y * x13; x30 -= l.z * x14; x30 -= l.w * x15; } { const v4f l = GDN_L4(30, 4); x30 -= l.x * x16; x30 -= l.y * x17; x30 -= l.z * x18; x30 -= l.w * x19; } { const v4f l = GDN_L4(30, 5); x30 -= l.x * x20; x30 -= l.y * x21; x30 -= l.z * x22; x30 -= l.w * x23; } { const v4f l = GDN_L4(30, 6); x30 -= l.x * x24; x30 -= l.y * x25; x30 -= l.z * x26; x30 -= l.w * x27; } { const v4f l = GDN_L4(30, 7); x30 -= l.x * x28; x30 -= l.y * x29; } __builtin_amdgcn_sched_barrier(0);
        float x31 = GDN_RHS(31); { const v4f l = GDN_L4(31, 0); x31 -= l.x * x0; x31 -= l.y * x1; x31 -= l.z * x2; x31 -= l.w * x3; } { const v4f l = GDN_L4(31, 1); x31 -= l.x * x4; x31 -= l.y * x5; x31 -= l.z * x6; x31 -= l.w * x7; } { const v4f l = GDN_L4(31, 2); x31 -= l.x * x8; x31 -= l.y * x9; x31 -= l.z * x10; x31 -= l.w * x11; } { const v4f l = GDN_L4(31, 3); x31 -= l.x * x12; x31 -= l.y * x13; x31 -= l.z * x14; x31 -= l.w * x15; } { const v4f l = GDN_L4(31, 4); x31 -= l.x * x16; x31 -= l.y * x17; x31 -= l.z * x18; x31 -= l.w * x19; } { const v4f l = GDN_L4(31, 5); x31 -= l.x * x20; x31 -= l.y * x21; x31 -= l.z * x22; x31 -= l.w * x23; } { const v4f l = GDN_L4(31, 6); x31 -= l.x * x24; x31 -= l.y * x25; x31 -= l.z * x26; x31 -= l.w * x27; } { const v4f l = GDN_L4(31, 7); x31 -= l.x * x28; x31 -= l.y * x29; x31 -= l.z * x30; } __builtin_amdgcn_sched_barrier(0);
        float x32 = GDN_RHS(32); { const v4f l = GDN_L4(32, 0); x32 -= l.x * x0; x32 -= l.y * x1; x32 -= l.z * x2; x32 -= l.w * x3; } { const v4f l = GDN_L4(32, 1); x32 -= l.x * x4; x32 -= l.y * x5; x32 -= l.z * x6; x32 -= l.w * x7; } { const v4f l = GDN_L4(32, 2); x32 -= l.x * x8; x32 -= l.y * x9; x32 -= l.z * x10; x32 -= l.w * x11; } { const v4f l = GDN_L4(32, 3); x32 -= l.x * x12; x32 -= l.y * x13; x32 -= l.z * x14; x32 -= l.w * x15; } { const v4f l = GDN_L4(32, 4); x32 -= l.x * x16; x32 -= l.y * x17; x32 -= l.z * x18; x32 -= l.w * x19; } { const v4f l = GDN_L4(32, 5); x32 -= l.x * x20; x32 -= l.y * x21; x32 -= l.z * x22; x32 -= l.w * x23; } { const v4f l = GDN_L4(32, 6); x32 -= l.x * x24; x32 -= l.y * x25; x32 -= l.z * x26; x32 -= l.w * x27; } { const v4f l = GDN_L4(32, 7); x32 -= l.x * x28; x32 -= l.y * x29; x32 -= l.z * x30; x32 -= l.w * x31; } __builtin_amdgcn_sched_barrier(0);
        float x33 = GDN_RHS(33); { const v4f l = GDN_L4(33, 0); x33 -= l.x * x0; x33 -= l.y * x1; x33 -= l.z * x2; x33 -= l.w * x3; } { const v4f l = GDN_L4(33, 1); x33 -= l.x * x4; x33 -= l.y * x5; x33 -= l.z * x6; x33 -= l.w * x7; } { const v4f l = GDN_L4(33, 2); x33 -= l.x * x8; x33 -= l.y * x9; x33 -= l.z * x10; x33 -= l.w * x11; } { const v4f l = GDN_L4(33, 3); x33 -= l.x * x12; x33 -= l.y * x13; x33 -= l.z * x14; x33 -= l.w * x15; } { const v4f l = GDN_L4(33, 4); x33 -= l.x * x16; x33 -= l.y * x17; x33 -= l.z * x18; x33 -= l.w * x19; } { const v4f l = GDN_L4(33, 5); x33 -= l.x * x20; x33 -= l.y * x21; x33 -= l.z * x22; x33 -= l.w * x23; } { const v4f l = GDN_L4(33, 6); x33 -= l.x * x24; x33 -= l.y * x25; x33 -= l.z * x26; x33 -= l.w * x27; } { const v4f l = GDN_L4(33, 7); x33 -= l.x * x28; x33 -= l.y * x29; x33 -= l.z * x30; x33 -= l.w * x31; } { const v4f l = GDN_L4(33, 8); x33 -= l.x * x32; } __builtin_amdgcn_sched_barrier(0);
        float x34 = GDN_RHS(34); { const v4f l = GDN_L4(34, 0); x34 -= l.x * x0; x34 -= l.y * x1; x34 -= l.z * x2; x34 -= l.w * x3; } { const v4f l = GDN_L4(34, 1); x34 -= l.x * x4; x34 -= l.y * x5; x34 -= l.z * x6; x34 -= l.w * x7; } { const v4f l = GDN_L4(34, 2); x34 -= l.x * x8; x34 -= l.y * x9; x34 -= l.z * x10; x34 -= l.w * x11; } { const v4f l = GDN_L4(34, 3); x34 -= l.x * x12; x34 -= l.y * x13; x34 -= l.z * x14; x34 -= l.w * x15; } { const v4f l = GDN_L4(34, 4); x34 -= l.x * x16; x34 -= l.y * x17; x34 -= l.z * x18; x34 -= l.w * x19; } { const v4f l = GDN_L4(34, 5); x34 -= l.x * x20; x34 -= l.y * x21; x34 -= l.z * x22; x34 -= l.w * x23; } { const v4f l = GDN_L4(34, 6); x34 -= l.x * x24; x34 -= l.y * x25; x34 -= l.z * x26; x34 -= l.w * x27; } { const v4f l = GDN_L4(34, 7); x34 -= l.x * x28; x34 -= l.y * x29; x34 -= l.z * x30; x34 -= l.w * x31; } { const v4f l = GDN_L4(34, 8); x34 -= l.x * x32; x34 -= l.y * x33; } __builtin_amdgcn_sched_barrier(0);
        float x35 = GDN_RHS(35); { const v4f l = GDN_L4(35, 0); x35 -= l.x * x0; x35 -= l.y * x1; x35 -= l.z * x2; x35 -= l.w * x3; } { const v4f l = GDN_L4(35, 1); x35 -= l.x * x4; x35 -= l.y * x5; x35 -= l.z * x6; x35 -= l.w * x7; } { const v4f l = GDN_L4(35, 2); x35 -= l.x * x8; x35 -= l.y * x9; x35 -= l.z * x10; x35 -= l.w * x11; } { const v4f l = GDN_L4(35, 3); x35 -= l.x * x12; x35 -= l.y * x13; x35 -= l.z * x14; x35 -= l.w * x15; } { const v4f l = GDN_L4(35, 4); x35 -= l.x * x16; x35 -= l.y * x17; x35 -= l.z * x18; x35 -= l.w * x19; } { const v4f l = GDN_L4(35, 5); x35 -= l.x * x20; x35 -= l.y * x21; x35 -= l.z * x22; x35 -= l.w * x23; } { const v4f l = GDN_L4(35, 6); x35 -= l.x * x24; x35 -= l.y * x25; x35 -= l.z * x26; x35 -= l.w * x27; } { const v4f l = GDN_L4(35, 7); x35 -= l.x * x28; x35 -= l.y * x29; x35 -= l.z * x30; x35 -= l.w * x31; } { const v4f l = GDN_L4(35, 8); x35 -= l.x * x32; x35 -= l.y * x33; x35 -= l.z * x34; } __builtin_amdgcn_sched_barrier(0);
        float x36 = GDN_RHS(36); { const v4f l = GDN_L4(36, 0); x36 -= l.x * x0; x36 -= l.y * x1; x36 -= l.z * x2; x36 -= l.w * x3; } { const v4f l = GDN_L4(36, 1); x36 -= l.x * x4; x36 -= l.y * x5; x36 -= l.z * x6; x36 -= l.w * x7; } { const v4f l = GDN_L4(36, 2); x36 -= l.x * x8; x36 -= l.y * x9; x36 -= l.z * x10; x36 -= l.w * x11; } { const v4f l = GDN_L4(36, 3); x36 -= l.x * x12; x36 -= l.y * x13; x36 -= l.z * x14; x36 -= l.w * x15; } { const v4f l = GDN_L4(36, 4); x36 -= l.x * x16; x36 -= l.y * x17; x36 -= l.z * x18; x36 -= l.w * x19; } { const v4f l = GDN_L4(36, 5); x36 -= l.x * x20; x36 -= l.y * x21; x36 -= l.z * x22; x36 -= l.w * x23; } { const v4f l = GDN_L4(36, 6); x36 -= l.x * x24; x36 -= l.y * x25; x36 -= l.z * x26; x36 -= l.w * x27; } { const v4f l = GDN_L4(36, 7); x36 -= l.x * x28; x36 -= l.y * x29; x36 -= l.z * x30; x36 -= l.w * x31; } { const v4f l = GDN_L4(36, 8); x36 -= l.x * x32; x36 -= l.y * x33; x36 -= l.z * x34; x36 -= l.w * x35; } __builtin_amdgcn_sched_barrier(0);
        float x37 = GDN_RHS(37); { const v4f l = GDN_L4(37, 0); x37 -= l.x * x0; x37 -= l.y * x1; x37 -= l.z * x2; x37 -= l.w * x3; } { const v4f l = GDN_L4(37, 1); x37 -= l.x * x4; x37 -= l.y * x5; x37 -= l.z * x6; x37 -= l.w * x7; } { const v4f l = GDN_L4(37, 2); x37 -= l.x * x8; x37 -= l.y * x9; x37 -= l.z * x10; x37 -= l.w * x11; } { const v4f l = GDN_L4(37, 3); x37 -= l.x * x12; x37 -= l.y * x13; x37 -= l.z * x14; x37 -= l.w * x15; } { const v4f l = GDN_L4(37, 4); x37 -= l.x * x16; x37 -= l.y * x17; x37 -= l.z * x18; x37 -= l.w * x19; } { const v4f l = GDN_L4(37, 5); x37 -= l.x * x20; x37 -= l.y * x21; x37 -= l.z * x22; x37 -= l.w * x23; } { const v4f l = GDN_L4(37, 6); x37 -= l.x * x24; x37 -= l.y * x25; x37 -= l.z * x26; x37 -= l.w * x27; } { const v4f l = GDN_L4(37, 7); x37 -= l.x * x28; x37 -= l.y * x29; x37 -= l.z * x30; x37 -= l.w * x31; } { const v4f l = GDN_L4(37, 8); x37 -= l.x * x32; x37 -= l.y * x33; x37 -= l.z * x34; x37 -= l.w * x35; } { const v4f l = GDN_L4(37, 9); x37 -= l.x * x36; } __builtin_amdgcn_sched_barrier(0);
        float x38 = GDN_RHS(38); { const v4f l = GDN_L4(38, 0); x38 -= l.x * x0; x38 -= l.y * x1; x38 -= l.z * x2; x38 -= l.w * x3; } { const v4f l = GDN_L4(38, 1); x38 -= l.x * x4; x38 -= l.y * x5; x38 -= l.z * x6; x38 -= l.w * x7; } { const v4f l = GDN_L4(38, 2); x38 -= l.x * x8; x38 -= l.y * x9; x38 -= l.z * x10; x38 -= l.w * x11; } { const v4f l = GDN_L4(38, 3); x38 -= l.x * x12; x38 -= l.y * x13; x38 -= l.z * x14; x38 -= l.w * x15; } { const v4f l = GDN_L4(38, 4); x38 -= l.x * x16; x38 -= l.y * x17; x38 -= l.z * x18; x38 -= l.w * x19; } { const v4f l = GDN_L4(38, 5); x38 -= l.x * x20; x38 -= l.y * x21; x38 -= l.z * x22; x38 -= l.w * x23; } { const v4f l = GDN_L4(38, 6); x38 -= l.x * x24; x38 -= l.y * x25; x38 -= l.z * x26; x38 -= l.w * x27; } { const v4f l = GDN_L4(38, 7); x38 -= l.x * x28; x38 -= l.y * x29; x38 -= l.z * x30; x38 -= l.w * x31; } { const v4f l = GDN_L4(38, 8); x38 -= l.x * x32; x38 -= l.y * x33; x38 -= l.z * x34; x38 -= l.w * x35; } { const v4f l = GDN_L4(38, 9); x38 -= l.x * x36; x38 -= l.y * x37; } __builtin_amdgcn_sched_barrier(0);
        float x39 = GDN_RHS(39); { const v4f l = GDN_L4(39, 0); x39 -= l.x * x0; x39 -= l.y * x1; x39 -= l.z * x2; x39 -= l.w * x3; } { const v4f l = GDN_L4(39, 1); x39 -= l.x * x4; x39 -= l.y * x5; x39 -= l.z * x6; x39 -= l.w * x7; } { const v4f l = GDN_L4(39, 2); x39 -= l.x * x8; x39 -= l.y * x9; x39 -= l.z * x10; x39 -= l.w * x11; } { const v4f l = GDN_L4(39, 3); x39 -= l.x * x12; x39 -= l.y * x13; x39 -= l.z * x14; x39 -= l.w * x15; } { const v4f l = GDN_L4(39, 4); x39 -= l.x * x16; x39 -= l.y * x17; x39 -= l.z * x18; x39 -= l.w * x19; } { const v4f l = GDN_L4(39, 5); x39 -= l.x * x20; x39 -= l.y * x21; x39 -= l.z * x22; x39 -= l.w * x23; } { const v4f l = GDN_L4(39, 6); x39 -= l.x * x24; x39 -= l.y * x25; x39 -= l.z * x26; x39 -= l.w * x27; } { const v4f l = GDN_L4(39, 7); x39 -= l.x * x28; x39 -= l.y * x29; x39 -= l.z * x30; x39 -= l.w * x31; } { const v4f l = GDN_L4(39, 8); x39 -= l.x * x32; x39 -= l.y * x33; x39 -= l.z * x34; x39 -= l.w * x35; } { const v4f l = GDN_L4(39, 9); x39 -= l.x * x36; x39 -= l.y * x37; x39 -= l.z * x38; } __builtin_amdgcn_sched_barrier(0);
        float x40 = GDN_RHS(40); { const v4f l = GDN_L4(40, 0); x40 -= l.x * x0; x40 -= l.y * x1; x40 -= l.z * x2; x40 -= l.w * x3; } { const v4f l = GDN_L4(40, 1); x40 -= l.x * x4; x40 -= l.y * x5; x40 -= l.z * x6; x40 -= l.w * x7; } { const v4f l = GDN_L4(40, 2); x40 -= l.x * x8; x40 -= l.y * x9; x40 -= l.z * x10; x40 -= l.w * x11; } { const v4f l = GDN_L4(40, 3); x40 -= l.x * x12; x40 -= l.y * x13; x40 -= l.z * x14; x40 -= l.w * x15; } { const v4f l = GDN_L4(40, 4); x40 -= l.x * x16; x40 -= l.y * x17; x40 -= l.z * x18; x40 -= l.w * x19; } { const v4f l = GDN_L4(40, 5); x40 -= l.x * x20; x40 -= l.y * x21; x40 -= l.z * x22; x40 -= l.w * x23; } { const v4f l = GDN_L4(40, 6); x40 -= l.x * x24; x40 -= l.y * x25; x40 -= l.z * x26; x40 -= l.w * x27; } { const v4f l = GDN_L4(40, 7); x40 -= l.x * x28; x40 -= l.y * x29; x40 -= l.z * x30; x40 -= l.w * x31; } { const v4f l = GDN_L4(40, 8); x40 -= l.x * x32; x40 -= l.y * x33; x40 -= l.z * x34; x40 -= l.w * x35; } { const v4f l = GDN_L4(40, 9); x40 -= l.x * x36; x40 -= l.y * x37; x40 -= l.z * x38; x40 -= l.w * x39; } __builtin_amdgcn_sched_barrier(0);
        float x41 = GDN_RHS(41); { const v4f l = GDN_L4(41, 0); x41 -= l.x * x0; x41 -= l.y * x1; x41 -= l.z * x2; x41 -= l.w * x3; } { const v4f l = GDN_L4(41, 1); x41 -= l.x * x4; x41 -= l.y * x5; x41 -= l.z * x6; x41 -= l.w * x7; } { const v4f l = GDN_L4(41, 2); x41 -= l.x * x8; x41 -= l.y * x9; x41 -= l.z * x10; x41 -= l.w * x11; } { const v4f l = GDN_L4(41, 3); x41 -= l.x * x12; x41 -= l.y * x13; x41 -= l.z * x14; x41 -= l.w * x15; } { const v4f l = GDN_L4(41, 4); x41 -= l.x * x16; x41 -= l.y * x17; x41 -= l.z * x18; x41 -= l.w * x19; } { const v4f l = GDN_L4(41, 5); x41 -= l.x * x20; x41 -= l.y * x21; x41 -= l.z * x22; x41 -= l.w * x23; } { const v4f l = GDN_L4(41, 6); x41 -= l.x * x24; x41 -= l.y * x25; x41 -= l.z * x26; x41 -= l.w * x27; } { const v4f l = GDN_L4(41, 7); x41 -= l.x * x28; x41 -= l.y * x29; x41 -= l.z * x30; x41 -= l.w * x31; } { const v4f l = GDN_L4(41, 8); x41 -= l.x * x32; x41 -= l.y * x33; x41 -= l.z * x34; x41 -= l.w * x35; } { const v4f l = GDN_L4(41, 9); x41 -= l.x * x36; x41 -= l.y * x37; x41 -= l.z * x38; x41 -= l.w * x39; } { const v4f l = GDN_L4(41, 10); x41 -= l.x * x40; } __builtin_amdgcn_sched_barrier(0);
        float x42 = GDN_RHS(42); { const v4f l = GDN_L4(42, 0); x42 -= l.x * x0; x42 -= l.y * x1; x42 -= l.z * x2; x42 -= l.w * x3; } { const v4f l = GDN_L4(42, 1); x42 -= l.x * x4; x42 -= l.y * x5; x42 -= l.z * x6; x42 -= l.w * x7; } { const v4f l = GDN_L4(42, 2); x42 -= l.x * x8; x42 -= l.y * x9; x42 -= l.z * x10; x42 -= l.w * x11; } { const v4f l = GDN_L4(42, 3); x42 -= l.x * x12; x42 -= l.y * x13; x42 -= l.z * x14; x42 -= l.w * x15; } { const v4f l = GDN_L4(42, 4); x42 -= l.x * x16; x42 -= l.y * x17; x42 -= l.z * x18; x42 -= l.w * x19; } { const v4f l = GDN_L4(42, 5); x42 -= l.x * x20; x42 -= l.y * x21; x42 -= l.z * x22; x42 -= l.w * x23; } { const v4f l = GDN_L4(42, 6); x42 -= l.x * x24; x42 -= l.y * x25; x42 -= l.z * x26; x42 -= l.w * x27; } { const v4f l = GDN_L4(42, 7); x42 -= l.x * x28; x42 -= l.y * x29; x42 -= l.z * x30; x42 -= l.w * x31; } { const v4f l = GDN_L4(42, 8); x42 -= l.x * x32; x42 -= l.y * x33; x42 -= l.z * x34; x42 -= l.w * x35; } { const v4f l = GDN_L4(42, 9); x42 -= l.x * x36; x42 -= l.y * x37; x42 -= l.z * x38; x42 -= l.w * x39; } { const v4f l = GDN_L4(42, 10); x42 -= l.x * x40; x42 -= l.y * x41; } __builtin_amdgcn_sched_barrier(0);
        float x43 = GDN_RHS(43); { const v4f l = GDN_L4(43, 0); x43 -= l.x * x0; x43 -= l.y * x1; x43 -= l.z * x2; x43 -= l.w * x3; } { const v4f l = GDN_L4(43, 1); x43 -= l.x * x4; x43 -= l.y * x5; x43 -= l.z * x6; x43 -= l.w * x7; } { const v4f l = GDN_L4(43, 2); x43 -= l.x * x8; x43 -= l.y * x9; x43 -= l.z * x10; x43 -= l.w * x11; } { const v4f l = GDN_L4(43, 3); x43 -= l.x * x12; x43 -= l.y * x13; x43 -= l.z * x14; x43 -= l.w * x15; } { const v4f l = GDN_L4(43, 4); x43 -= l.x * x16; x43 -= l.y * x17; x43 -= l.z * x18; x43 -= l.w * x19; } { const v4f l = GDN_L4(43, 5); x43 -= l.x * x20; x43 -= l.y * x21; x43 -= l.z * x22; x43 -= l.w * x23; } { const v4f l = GDN_L4(43, 6); x43 -= l.x * x24; x43 -= l.y * x25; x43 -= l.z * x26; x43 -= l.w * x27; } { const v4f l = GDN_L4(43, 7); x43 -= l.x * x28; x43 -= l.y * x29; x43 -= l.z * x30; x43 -= l.w * x31; } { const v4f l = GDN_L4(43, 8); x43 -= l.x * x32; x43 -= l.y * x33; x43 -= l.z * x34; x43 -= l.w * x35; } { const v4f l = GDN_L4(43, 9); x43 -= l.x * x36; x43 -= l.y * x37; x43 -= l.z * x38; x43 -= l.w * x39; } { const v4f l = GDN_L4(43, 10); x43 -= l.x * x40; x43 -= l.y * x41; x43 -= l.z * x42; } __builtin_amdgcn_sched_barrier(0);
        float x44 = GDN_RHS(44); { const v4f l = GDN_L4(44, 0); x44 -= l.x * x0; x44 -= l.y * x1; x44 -= l.z * x2; x44 -= l.w * x3; } { const v4f l = GDN_L4(44, 1); x44 -= l.x * x4; x44 -= l.y * x5; x44 -= l.z * x6; x44 -= l.w * x7; } { const v4f l = GDN_L4(44, 2); x44 -= l.x * x8; x44 -= l.y * x9; x44 -= l.z * x10; x44 -= l.w * x11; } { const v4f l = GDN_L4(44, 3); x44 -= l.x * x12; x44 -= l.y * x13; x44 -= l.z * x14; x44 -= l.w * x15; } { const v4f l = GDN_L4(44, 4); x44 -= l.x * x16; x44 -= l.y * x17; x44 -= l.z * x18; x44 -= l.w * x19; } { const v4f l = GDN_L4(44, 5); x44 -= l.x * x20; x44 -= l.y * x21; x44 -= l.z * x22; x44 -= l.w * x23; } { const v4f l = GDN_L4(44, 6); x44 -= l.x * x24; x44 -= l.y * x25; x44 -= l.z * x26; x44 -= l.w * x27; } { const v4f l = GDN_L4(44, 7); x44 -= l.x * x28; x44 -= l.y * x29; x44 -= l.z * x30; x44 -= l.w * x31; } { const v4f l = GDN_L4(44, 8); x44 -= l.x * x32; x44 -= l.y * x33; x44 -= l.z * x34; x44 -= l.w * x35; } { const v4f l = GDN_L4(44, 9); x44 -= l.x * x36; x44 -= l.y * x37; x44 -= l.z * x38; x44 -= l.w * x39; } { const v4f l = GDN_L4(44, 10); x44 -= l.x * x40; x44 -= l.y * x41; x44 -= l.z * x42; x44 -= l.w * x43; } __builtin_amdgcn_sched_barrier(0);
        float x45 = GDN_RHS(45); { const v4f l = GDN_L4(45, 0); x45 -= l.x * x0; x45 -= l.y * x1; x45 -= l.z * x2; x45 -= l.w * x3; } { const v4f l = GDN_L4(45, 1); x45 -= l.x * x4; x45 -= l.y * x5; x45 -= l.z * x6; x45 -= l.w * x7; } { const v4f l = GDN_L4(45, 2); x45 -= l.x * x8; x45 -= l.y * x9; x45 -= l.z * x10; x45 -= l.w * x11; } { const v4f l = GDN_L4(45, 3); x45 -= l.x * x12; x45 -= l.y * x13; x45 -= l.z * x14; x45 -= l.w * x15; } { const v4f l = GDN_L4(45, 4); x45 -= l.x * x16; x45 -= l.y * x17; x45 -= l.z * x18; x45 -= l.w * x19; } { const v4f l = GDN_L4(45, 5); x45 -= l.x * x20; x45 -= l.y * x21; x45 -= l.z * x22; x45 -= l.w * x23; } { const v4f l = GDN_L4(45, 6); x45 -= l.x * x24; x45 -= l.y * x25; x45 -= l.z * x26; x45 -= l.w * x27; } { const v4f l = GDN_L4(45, 7); x45 -= l.x * x28; x45 -= l.y * x29; x45 -= l.z * x30; x45 -= l.w * x31; } { const v4f l = GDN_L4(45, 8); x45 -= l.x * x32; x45 -= l.y * x33; x45 -= l.z * x34; x45 -= l.w * x35; } { const v4f l = GDN_L4(45, 9); x45 -= l.x * x36; x45 -= l.y * x37; x45 -= l.z * x38; x45 -= l.w * x39; } { const v4f l = GDN_L4(45, 10); x45 -= l.x * x40; x45 -= l.y * x41; x45 -= l.z * x42; x45 -= l.w * x43; } { const v4f l = GDN_L4(45, 11); x45 -= l.x * x44; } __builtin_amdgcn_sched_barrier(0);
        float x46 = GDN_RHS(46); { const v4f l = GDN_L4(46, 0); x46 -= l.x * x0; x46 -= l.y * x1; x46 -= l.z * x2; x46 -= l.w * x3; } { const v4f l = GDN_L4(46, 1); x46 -= l.x * x4; x46 -= l.y * x5; x46 -= l.z * x6; x46 -= l.w * x7; } { const v4f l = GDN_L4(46, 2); x46 -= l.x * x8; x46 -= l.y * x9; x46 -= l.z * x10; x46 -= l.w * x11; } { const v4f l = GDN_L4(46, 3); x46 -= l.x * x12; x46 -= l.y * x13; x46 -= l.z * x14; x46 -= l.w * x15; } { const v4f l = GDN_L4(46, 4); x46 -= l.x * x16; x46 -= l.y * x17; x46 -= l.z * x18; x46 -= l.w * x19; } { const v4f l = GDN_L4(46, 5); x46 -= l.x * x20; x46 -= l.y * x21; x46 -= l.z * x22; x46 -= l.w * x23; } { const v4f l = GDN_L4(46, 6); x46 -= l.x * x24; x46 -= l.y * x25; x46 -= l.z * x26; x46 -= l.w * x27; } { const v4f l = GDN_L4(46, 7); x46 -= l.x * x28; x46 -= l.y * x29; x46 -= l.z * x30; x46 -= l.w * x31; } { const v4f l = GDN_L4(46, 8); x46 -= l.x * x32; x46 -= l.y * x33; x46 -= l.z * x34; x46 -= l.w * x35; } { const v4f l = GDN_L4(46, 9); x46 -= l.x * x36; x46 -= l.y * x37; x46 -= l.z * x38; x46 -= l.w * x39; } { const v4f l = GDN_L4(46, 10); x46 -= l.x * x40; x46 -= l.y * x41; x46 -= l.z * x42; x46 -= l.w * x43; } { const v4f l = GDN_L4(46, 11); x46 -= l.x * x44; x46 -= l.y * x45; } __builtin_amdgcn_sched_barrier(0);
        float x47 = GDN_RHS(47); { const v4f l = GDN_L4(47, 0); x47 -= l.x * x0; x47 -= l.y * x1; x47 -= l.z * x2; x47 -= l.w * x3; } { const v4f l = GDN_L4(47, 1); x47 -= l.x * x4; x47 -= l.y * x5; x47 -= l.z * x6; x47 -= l.w * x7; } { const v4f l = GDN_L4(47, 2); x47 -= l.x * x8; x47 -= l.y * x9; x47 -= l.z * x10; x47 -= l.w * x11; } { const v4f l = GDN_L4(47, 3); x47 -= l.x * x12; x47 -= l.y * x13; x47 -= l.z * x14; x47 -= l.w * x15; } { const v4f l = GDN_L4(47, 4); x47 -= l.x * x16; x47 -= l.y * x17; x47 -= l.z * x18; x47 -= l.w * x19; } { const v4f l = GDN_L4(47, 5); x47 -= l.x * x20; x47 -= l.y * x21; x47 -= l.z * x22; x47 -= l.w * x23; } { const v4f l = GDN_L4(47, 6); x47 -= l.x * x24; x47 -= l.y * x25; x47 -= l.z * x26; x47 -= l.w * x27; } { const v4f l = GDN_L4(47, 7); x47 -= l.x * x28; x47 -= l.y * x29; x47 -= l.z * x30; x47 -= l.w * x31; } { const v4f l = GDN_L4(47, 8); x47 -= l.x * x32; x47 -= l.y * x33; x47 -= l.z * x34; x47 -= l.w * x35; } { const v4f l = GDN_L4(47, 9); x47 -= l.x * x36; x47 -= l.y * x37; x47 -= l.z * x38; x47 -= l.w * x39; } { const v4f l = GDN_L4(47, 10); x47 -= l.x * x40; x47 -= l.y * x41; x47 -= l.z * x42; x47 -= l.w * x43; } { const v4f l = GDN_L4(47, 11); x47 -= l.x * x44; x47 -= l.y * x45; x47 -= l.z * x46; } __builtin_amdgcn_sched_barrier(0);
        float x48 = GDN_RHS(48); { const v4f l = GDN_L4(48, 0); x48 -= l.x * x0; x48 -= l.y * x1; x48 -= l.z * x2; x48 -= l.w * x3; } { const v4f l = GDN_L4(48, 1); x48 -= l.x * x4; x48 -= l.y * x5; x48 -= l.z * x6; x48 -= l.w * x7; } { const v4f l = GDN_L4(48, 2); x48 -= l.x * x8; x48 -= l.y * x9; x48 -= l.z * x10; x48 -= l.w * x11; } { const v4f l = GDN_L4(48, 3); x48 -= l.x * x12; x48 -= l.y * x13; x48 -= l.z * x14; x48 -= l.w * x15; } { const v4f l = GDN_L4(48, 4); x48 -= l.x * x16; x48 -= l.y * x17; x48 -= l.z * x18; x48 -= l.w * x19; } { const v4f l = GDN_L4(48, 5); x48 -= l.x * x20; x48 -= l.y * x21; x48 -= l.z * x22; x48 -= l.w * x23; } { const v4f l = GDN_L4(48, 6); x48 -= l.x * x24; x48 -= l.y * x25; x48 -= l.z * x26; x48 -= l.w * x27; } { const v4f l = GDN_L4(48, 7); x48 -= l.x * x28; x48 -= l.y * x29; x48 -= l.z * x30; x48 -= l.w * x31; } { const v4f l = GDN_L4(48, 8); x48 -= l.x * x32; x48 -= l.y * x33; x48 -= l.z * x34; x48 -= l.w * x35; } { const v4f l = GDN_L4(48, 9); x48 -= l.x * x36; x48 -= l.y * x37; x48 -= l.z * x38; x48 -= l.w * x39; } { const v4f l = GDN_L4(48, 10); x48 -= l.x * x40; x48 -= l.y * x41; x48 -= l.z * x42; x48 -= l.w * x43; } { const v4f l = GDN_L4(48, 11); x48 -= l.x * x44; x48 -= l.y * x45; x48 -= l.z * x46; x48 -= l.w * x47; } __builtin_amdgcn_sched_barrier(0);
        float x49 = GDN_RHS(49); { const v4f l = GDN_L4(49, 0); x49 -= l.x * x0; x49 -= l.y * x1; x49 -= l.z * x2; x49 -= l.w * x3; } { const v4f l = GDN_L4(49, 1); x49 -= l.x * x4; x49 -= l.y * x5; x49 -= l.z * x6; x49 -= l.w * x7; } { const v4f l = GDN_L4(49, 2); x49 -= l.x * x8; x49 -= l.y * x9; x49 -= l.z * x10; x49 -= l.w * x11; } { const v4f l = GDN_L4(49, 3); x49 -= l.x * x12; x49 -= l.y * x13; x49 -= l.z * x14; x49 -= l.w * x15; } { const v4f l = GDN_L4(49, 4); x49 -= l.x * x16; x49 -= l.y * x17; x49 -= l.z * x18; x49 -= l.w * x19; } { const v4f l = GDN_L4(49, 5); x49 -= l.x * x20; x49 -= l.y * x21; x49 -= l.z * x22; x49 -= l.w * x23; } { const v4f l = GDN_L4(49, 6); x49 -= l.x * x24; x49 -= l.y * x25; x49 -= l.z * x26; x49 -= l.w * x27; } { const v4f l = GDN_L4(49, 7); x49 -= l.x * x28; x49 -= l.y * x29; x49 -= l.z * x30; x49 -= l.w * x31; } { const v4f l = GDN_L4(49, 8); x49 -= l.x * x32; x49 -= l.y * x33; x49 -= l.z * x34; x49 -= l.w * x35; } { const v4f l = GDN_L4(49, 9); x49 -= l.x * x36; x49 -= l.y * x37; x49 -= l.z * x38; x49 -= l.w * x39; } { const v4f l = GDN_L4(49, 10); x49 -= l.x * x40; x49 -= l.y * x41; x49 -= l.z * x42; x49 -= l.w * x43; } { const v4f l = GDN_L4(49, 11); x49 -= l.x * x44; x49 -= l.y * x45; x49 -= l.z * x46; x49 -= l.w * x47; } { const v4f l = GDN_L4(49, 12); x49 -= l.x * x48; } __builtin_amdgcn_sched_barrier(0);
        float x50 = GDN_RHS(50); { const v4f l = GDN_L4(50, 0); x50 -= l.x * x0; x50 -= l.y * x1; x50 -= l.z * x2; x50 -= l.w * x3; } { const v4f l = GDN_L4(50, 1); x50 -= l.x * x4; x50 -= l.y * x5; x50 -= l.z * x6; x50 -= l.w * x7; } { const v4f l = GDN_L4(50, 2); x50 -= l.x * x8; x50 -= l.y * x9; x50 -= l.z * x10; x50 -= l.w * x11; } { const v4f l = GDN_L4(50, 3); x50 -= l.x * x12; x50 -= l.y * x13; x50 -= l.z * x14; x50 -= l.w * x15; } { const v4f l = GDN_L4(50, 4); x50 -= l.x * x16; x50 -= l.y * x17; x50 -= l.z * x18; x50 -= l.w * x19; } { const v4f l = GDN_L4(50, 5); x50 -= l.x * x20; x50 -= l.y * x21; x50 -= l.z * x22; x50 -= l.w * x23; } { const v4f l = GDN_L4(50, 6); x50 -= l.x * x24; x50 -= l.y * x25; x50 -= l.z * x26; x50 -= l.w * x27; } { const v4f l = GDN_L4(50, 7); x50 -= l.x * x28; x50 -= l.y * x29; x50 -= l.z * x30; x50 -= l.w * x31; } { const v4f l = GDN_L4(50, 8); x50 -= l.x * x32; x50 -= l.y * x33; x50 -= l.z * x34; x50 -= l.w * x35; } { const v4f l = GDN_L4(50, 9); x50 -= l.x * x36; x50 -= l.y * x37; x50 -= l.z * x38; x50 -= l.w * x39; } { const v4f l = GDN_L4(50, 10); x50 -= l.x * x40; x50 -= l.y * x41; x50 -= l.z * x42; x50 -= l.w * x43; } { const v4f l = GDN_L4(50, 11); x50 -= l.x * x44; x50 -= l.y * x45; x50 -= l.z * x46; x50 -= l.w * x47; } { const v4f l = GDN_L4(50, 12); x50 -= l.x * x48; x50 -= l.y * x49; } __builtin_amdgcn_sched_barrier(0);
        float x51 = GDN_RHS(51); { const v4f l = GDN_L4(51, 0); x51 -= l.x * x0; x51 -= l.y * x1; x51 -= l.z * x2; x51 -= l.w * x3; } { const v4f l = GDN_L4(51, 1); x51 -= l.x * x4; x51 -= l.y * x5; x51 -= l.z * x6; x51 -= l.w * x7; } { const v4f l = GDN_L4(51, 2); x51 -= l.x * x8; x51 -= l.y * x9; x51 -= l.z * x10; x51 -= l.w * x11; } { const v4f l = GDN_L4(51, 3); x51 -= l.x * x12; x51 -= l.y * x13; x51 -= l.z * x14; x51 -= l.w * x15; } { const v4f l = GDN_L4(51, 4); x51 -= l.x * x16; x51 -= l.y * x17; x51 -= l.z * x18; x51 -= l.w * x19; } { const v4f l = GDN_L4(51, 5); x51 -= l.x * x20; x51 -= l.y * x21; x51 -= l.z * x22; x51 -= l.w * x23; } { const v4f l = GDN_L4(51, 6); x51 -= l.x * x24; x51 -= l.y * x25; x51 -= l.z * x26; x51 -= l.w * x27; } { const v4f l = GDN_L4(51, 7); x51 -= l.x * x28; x51 -= l.y * x29; x51 -= l.z * x30; x51 -= l.w * x31; } { const v4f l = GDN_L4(51, 8); x51 -= l.x * x32; x51 -= l.y * x33; x51 -= l.z * x34; x51 -= l.w * x35; } { const v4f l = GDN_L4(51, 9); x51 -= l.x * x36; x51 -= l.y * x37; x51 -= l.z * x38; x51 -= l.w * x39; } { const v4f l = GDN_L4(51, 10); x51 -= l.x * x40; x51 -= l.y * x41; x51 -= l.z * x42; x51 -= l.w * x43; } { const v4f l = GDN_L4(51, 11); x51 -= l.x * x44; x51 -= l.y * x45; x51 -= l.z * x46; x51 -= l.w * x47; } { const v4f l = GDN_L4(51, 12); x51 -= l.x * x48; x51 -= l.y * x49; x51 -= l.z * x50; } __builtin_amdgcn_sched_barrier(0);
        float x52 = GDN_RHS(52); { const v4f l = GDN_L4(52, 0); x52 -= l.x * x0; x52 -= l.y * x1; x52 -= l.z * x2; x52 -= l.w * x3; } { const v4f l = GDN_L4(52, 1); x52 -= l.x * x4; x52 -= l.y * x5; x52 -= l.z * x6; x52 -= l.w * x7; } { const v4f l = GDN_L4(52, 2); x52 -= l.x * x8; x52 -= l.y * x9; x52 -= l.z * x10; x52 -= l.w * x11; } { const v4f l = GDN_L4(52, 3); x52 -= l.x * x12; x52 -= l.y * x13; x52 -= l.z * x14; x52 -= l.w * x15; } { const v4f l = GDN_L4(52, 4); x52 -= l.x * x16; x52 -= l.y * x17; x52 -= l.z * x18; x52 -= l.w * x19; } { const v4f l = GDN_L4(52, 5); x52 -= l.x * x20; x52 -= l.y * x21; x52 -= l.z * x22; x52 -= l.w * x23; } { const v4f l = GDN_L4(52, 6); x52 -= l.x * x24; x52 -= l.y * x25; x52 -= l.z * x26; x52 -= l.w * x27; } { const v4f l = GDN_L4(52, 7); x52 -= l.x * x28; x52 -= l.y * x29; x52 -= l.z * x30; x52 -= l.w * x31; } { const v4f l = GDN_L4(52, 8); x52 -= l.x * x32; x52 -= l.y * x33; x52 -= l.z * x34; x52 -= l.w * x35; } { const v4f l = GDN_L4(52, 9); x52 -= l.x * x36; x52 -= l.y * x37; x52 -= l.z * x38; x52 -= l.w * x39; } { const v4f l = GDN_L4(52, 10); x52 -= l.x * x40; x52 -= l.y * x41; x52 -= l.z * x42; x52 -= l.w * x43; } { const v4f l = GDN_L4(52, 11); x52 -= l.x * x44; x52 -= l.y * x45; x52 -= l.z * x46; x52 -= l.w * x47; } { const v4f l = GDN_L4(52, 12); x52 -= l.x * x48; x52 -= l.y * x49; x52 -= l.z * x50; x52 -= l.w * x51; } __builtin_amdgcn_sched_barrier(0);
        float x53 = GDN_RHS(53); { const v4f l = GDN_L4(53, 0); x53 -= l.x * x0; x53 -= l.y * x1; x53 -= l.z * x2; x53 -= l.w * x3; } { const v4f l = GDN_L4(53, 1); x53 -= l.x * x4; x53 -= l.y * x5; x53 -= l.z * x6; x53 -= l.w * x7; } { const v4f l = GDN_L4(53, 2); x53 -= l.x * x8; x53 -= l.y * x9; x53 -= l.z * x10; x53 -= l.w * x11; } { const v4f l = GDN_L4(53, 3); x53 -= l.x * x12; x53 -= l.y * x13; x53 -= l.z * x14; x53 -= l.w * x15; } { const v4f l = GDN_L4(53, 4); x53 -= l.x * x16; x53 -= l.y * x17; x53 -= l.z * x18; x53 -= l.w * x19; } { const v4f l = GDN_L4(53, 5); x53 -= l.x * x20; x53 -= l.y * x21; x53 -= l.z * x22; x53 -= l.w * x23; } { const v4f l = GDN_L4(53, 6); x53 -= l.x * x24; x53 -= l.y * x25; x53 -= l.z * x26; x53 -= l.w * x27; } { const v4f l = GDN_L4(53, 7); x53 -= l.x * x28; x53 -= l.y * x29; x53 -= l.z * x30; x53 -= l.w * x31; } { const v4f l = GDN_L4(53, 8); x53 -= l.x * x32; x53 -= l.y * x33; x53 -= l.z * x34; x53 -= l.w * x35; } { const v4f l = GDN_L4(53, 9); x53 -= l.x * x36; x53 -= l.y * x37; x53 -= l.z * x38; x53 -= l.w * x39; } { const v4f l = GDN_L4(53, 10); x53 -= l.x * x40; x53 -= l.y * x41; x53 -= l.z * x42; x53 -= l.w * x43; } { const v4f l = GDN_L4(53, 11); x53 -= l.x * x44; x53 -= l.y * x45; x53 -= l.z * x46; x53 -= l.w * x47; } { const v4f l = GDN_L4(53, 12); x53 -= l.x * x48; x53 -= l.y * x49; x53 -= l.z * x50; x53 -= l.w * x51; } { const v4f l = GDN_L4(53, 13); x53 -= l.x * x52; } __builtin_amdgcn_sched_barrier(0);
        float x54 = GDN_RHS(54); { const v4f l = GDN_L4(54, 0); x54 -= l.x * x0; x54 -= l.y * x1; x54 -= l.z * x2; x54 -= l.w * x3; } { const v4f l = GDN_L4(54, 1); x54 -= l.x * x4; x54 -= l.y * x5; x54 -= l.z * x6; x54 -= l.w * x7; } { const v4f l = GDN_L4(54, 2); x54 -= l.x * x8; x54 -= l.y * x9; x54 -= l.z * x10; x54 -= l.w * x11; } { const v4f l = GDN_L4(54, 3); x54 -= l.x * x12; x54 -= l.y * x13; x54 -= l.z * x14; x54 -= l.w * x15; } { const v4f l = GDN_L4(54, 4); x54 -= l.x * x16; x54 -= l.y * x17; x54 -= l.z * x18; x54 -= l.w * x19; } { const v4f l = GDN_L4(54, 5); x54 -= l.x * x20; x54 -= l.y * x21; x54 -= l.z * x22; x54 -= l.w * x23; } { const v4f l = GDN_L4(54, 6); x54 -= l.x * x24; x54 -= l.y * x25; x54 -= l.z * x26; x54 -= l.w * x27; } { const v4f l = GDN_L4(54, 7); x54 -= l.x * x28; x54 -= l.y * x29; x54 -= l.z * x30; x54 -= l.w * x31; } { const v4f l = GDN_L4(54, 8); x54 -= l.x * x32; x54 -= l.y * x33; x54 -= l.z * x34; x54 -= l.w * x35; } { const v4f l = GDN_L4(54, 9); x54 -= l.x * x36; x54 -= l.y * x37; x54 -= l.z * x38; x54 -= l.w * x39; } { const v4f l = GDN_L4(54, 10); x54 -= l.x * x40; x54 -= l.y * x41; x54 -= l.z * x42; x54 -= l.w * x43; } { const v4f l = GDN_L4(54, 11); x54 -= l.x * x44; x54 -= l.y * x45; x54 -= l.z * x46; x54 -= l.w * x47; } { const v4f l = GDN_L4(54, 12); x54 -= l.x * x48; x54 -= l.y * x49; x54 -= l.z * x50; x54 -= l.w * x51; } { const v4f l = GDN_L4(54, 13); x54 -= l.x * x52; x54 -= l.y * x53; } __builtin_amdgcn_sched_barrier(0);
        float x55 = GDN_RHS(55); { const v4f l = GDN_L4(55, 0); x55 -= l.x * x0; x55 -= l.y * x1; x55 -= l.z * x2; x55 -= l.w * x3; } { const v4f l = GDN_L4(55, 1); x55 -= l.x * x4; x55 -= l.y * x5; x55 -= l.z * x6; x55 -= l.w * x7; } { const v4f l = GDN_L4(55, 2); x55 -= l.x * x8; x55 -= l.y * x9; x55 -= l.z * x10; x55 -= l.w * x11; } { const v4f l = GDN_L4(55, 3); x55 -= l.x * x12; x55 -= l.y * x13; x55 -= l.z * x14; x55 -= l.w * x15; } { const v4f l = GDN_L4(55, 4); x55 -= l.x * x16; x55 -= l.y * x17; x55 -= l.z * x18; x55 -= l.w * x19; } { const v4f l = GDN_L4(55, 5); x55 -= l.x * x20; x55 -= l.y * x21; x55 -= l.z * x22; x55 -= l.w * x23; } { const v4f l = GDN_L4(55, 6); x55 -= l.x * x24; x55 -= l.y * x25; x55 -= l.z * x26; x55 -= l.w * x27; } { const v4f l = GDN_L4(55, 7); x55 -= l.x * x28; x55 -= l.y * x29; x55 -= l.z * x30; x55 -= l.w * x31; } { const v4f l = GDN_L4(55, 8); x55 -= l.x * x32; x55 -= l.y * x33; x55 -= l.z * x34; x55 -= l.w * x35; } { const v4f l = GDN_L4(55, 9); x55 -= l.x * x36; x55 -= l.y * x37; x55 -= l.z * x38; x55 -= l.w * x39; } { const v4f l = GDN_L4(55, 10); x55 -= l.x * x40; x55 -= l.y * x41; x55 -= l.z * x42; x55 -= l.w * x43; } { const v4f l = GDN_L4(55, 11); x55 -= l.x * x44; x55 -= l.y * x45; x55 -= l.z * x46; x55 -= l.w * x47; } { const v4f l = GDN_L4(55, 12); x55 -= l.x * x48; x55 -= l.y * x49; x55 -= l.z * x50; x55 -= l.w * x51; } { const v4f l = GDN_L4(55, 13); x55 -= l.x * x52; x55 -= l.y * x53; x55 -= l.z * x54; } __builtin_amdgcn_sched_barrier(0);
        float x56 = GDN_RHS(56); { const v4f l = GDN_L4(56, 0); x56 -= l.x * x0; x56 -= l.y * x1; x56 -= l.z * x2; x56 -= l.w * x3; } { const v4f l = GDN_L4(56, 1); x56 -= l.x * x4; x56 -= l.y * x5; x56 -= l.z * x6; x56 -= l.w * x7; } { const v4f l = GDN_L4(56, 2); x56 -= l.x * x8; x56 -= l.y * x9; x56 -= l.z * x10; x56 -= l.w * x11; } { const v4f l = GDN_L4(56, 3); x56 -= l.x * x12; x56 -= l.y * x13; x56 -= l.z * x14; x56 -= l.w * x15; } { const v4f l = GDN_L4(56, 4); x56 -= l.x * x16; x56 -= l.y * x17; x56 -= l.z * x18; x56 -= l.w * x19; } { const v4f l = GDN_L4(56, 5); x56 -= l.x * x20; x56 -= l.y * x21; x56 -= l.z * x22; x56 -= l.w * x23; } { const v4f l = GDN_L4(56, 6); x56 -= l.x * x24; x56 -= l.y * x25; x56 -= l.z * x26; x56 -= l.w * x27; } { const v4f l = GDN_L4(56, 7); x56 -= l.x * x28; x56 -= l.y * x29; x56 -= l.z * x30; x56 -= l.w * x31; } { const v4f l = GDN_L4(56, 8); x56 -= l.x * x32; x56 -= l.y * x33; x56 -= l.z * x34; x56 -= l.w * x35; } { const v4f l = GDN_L4(56, 9); x56 -= l.x * x36; x56 -= l.y * x37; x56 -= l.z * x38; x56 -= l.w * x39; } { const v4f l = GDN_L4(56, 10); x56 -= l.x * x40; x56 -= l.y * x41; x56 -= l.z * x42; x56 -= l.w * x43; } { const v4f l = GDN_L4(56, 11); x56 -= l.x * x44; x56 -= l.y * x45; x56 -= l.z * x46; x56 -= l.w * x47; } { const v4f l = GDN_L4(56, 12); x56 -= l.x * x48; x56 -= l.y * x49; x56 -= l.z * x50; x56 -= l.w * x51; } { const v4f l = GDN_L4(56, 13); x56 -= l.x * x52; x56 -= l.y * x53; x56 -= l.z * x54; x56 -= l.w * x55; } __builtin_amdgcn_sched_barrier(0);
        float x57 = GDN_RHS(57); { const v4f l = GDN_L4(57, 0); x57 -= l.x * x0; x57 -= l.y * x1; x57 -= l.z * x2; x57 -= l.w * x3; } { const v4f l = GDN_L4(57, 1); x57 -= l.x * x4; x57 -= l.y * x5; x57 -= l.z * x6; x57 -= l.w * x7; } { const v4f l = GDN_L4(57, 2); x57 -= l.x * x8; x57 -= l.y * x9; x57 -= l.z * x10; x57 -= l.w * x11; } { const v4f l = GDN_L4(57, 3); x57 -= l.x * x12; x57 -= l.y * x13; x57 -= l.z * x14; x57 -= l.w * x15; } { const v4f l = GDN_L4(57, 4); x57 -= l.x * x16; x57 -= l.y * x17; x57 -= l.z * x18; x57 -= l.w * x19; } { const v4f l = GDN_L4(57, 5); x57 -= l.x * x20; x57 -= l.y * x21; x57 -= l.z * x22; x57 -= l.w * x23; } { const v4f l = GDN_L4(57, 6); x57 -= l.x * x24; x57 -= l.y * x25; x57 -= l.z * x26; x57 -= l.w * x27; } { const v4f l = GDN_L4(57, 7); x57 -= l.x * x28; x57 -= l.y * x29; x57 -= l.z * x30; x57 -= l.w * x31; } { const v4f l = GDN_L4(57, 8); x57 -= l.x * x32; x57 -= l.y * x33; x57 -= l.z * x34; x57 -= l.w * x35; } { const v4f l = GDN_L4(57, 9); x57 -= l.x * x36; x57 -= l.y * x37; x57 -= l.z * x38; x57 -= l.w * x39; } { const v4f l = GDN_L4(57, 10); x57 -= l.x * x40; x57 -= l.y * x41; x57 -= l.z * x42; x57 -= l.w * x43; } { const v4f l = GDN_L4(57, 11); x57 -= l.x * x44; x57 -= l.y * x45; x57 -= l.z * x46; x57 -= l.w * x47; } { const v4f l = GDN_L4(57, 12); x57 -= l.x * x48; x57 -= l.y * x49; x57 -= l.z * x50; x57 -= l.w * x51; } { const v4f l = GDN_L4(57, 13); x57 -= l.x * x52; x57 -= l.y * x53; x57 -= l.z * x54; x57 -= l.w * x55; } { const v4f l = GDN_L4(57, 14); x57 -= l.x * x56; } __builtin_amdgcn_sched_barrier(0);
        float x58 = GDN_RHS(58); { const v4f l = GDN_L4(58, 0); x58 -= l.x * x0; x58 -= l.y * x1; x58 -= l.z * x2; x58 -= l.w * x3; } { const v4f l = GDN_L4(58, 1); x58 -= l.x * x4; x58 -= l.y * x5; x58 -= l.z * x6; x58 -= l.w * x7; } { const v4f l = GDN_L4(58, 2); x58 -= l.x * x8; x58 -= l.y * x9; x58 -= l.z * x10; x58 -= l.w * x11; } { const v4f l = GDN_L4(58, 3); x58 -= l.x * x12; x58 -= l.y * x13; x58 -= l.z * x14; x58 -= l.w * x15; } { const v4f l = GDN_L4(58, 4); x58 -= l.x * x16; x58 -= l.y * x17; x58 -= l.z * x18; x58 -= l.w * x19; } { const v4f l = GDN_L4(58, 5); x58 -= l.x * x20; x58 -= l.y * x21; x58 -= l.z * x22; x58 -= l.w * x23; } { const v4f l = GDN_L4(58, 6); x58 -= l.x * x24; x58 -= l.y * x25; x58 -= l.z * x26; x58 -= l.w * x27; } { const v4f l = GDN_L4(58, 7); x58 -= l.x * x28; x58 -= l.y * x29; x58 -= l.z * x30; x58 -= l.w * x31; } { const v4f l = GDN_L4(58, 8); x58 -= l.x * x32; x58 -= l.y * x33; x58 -= l.z * x34; x58 -= l.w * x35; } { const v4f l = GDN_L4(58, 9); x58 -= l.x * x36; x58 -= l.y * x37; x58 -= l.z * x38; x58 -= l.w * x39; } { const v4f l = GDN_L4(58, 10); x58 -= l.x * x40; x58 -= l.y * x41; x58 -= l.z * x42; x58 -= l.w * x43; } { const v4f l = GDN_L4(58, 11); x58 -= l.x * x44; x58 -= l.y * x45; x58 -= l.z * x46; x58 -= l.w * x47; } { const v4f l = GDN_L4(58, 12); x58 -= l.x * x48; x58 -= l.y * x49; x58 -= l.z * x50; x58 -= l.w * x51; } { const v4f l = GDN_L4(58, 13); x58 -= l.x * x52; x58 -= l.y * x53; x58 -= l.z * x54; x58 -= l.w * x55; } { const v4f l = GDN_L4(58, 14); x58 -= l.x * x56; x58 -= l.y * x57; } __builtin_amdgcn_sched_barrier(0);
        float x59 = GDN_RHS(59); { const v4f l = GDN_L4(59, 0); x59 -= l.x * x0; x59 -= l.y * x1; x59 -= l.z * x2; x59 -= l.w * x3; } { const v4f l = GDN_L4(59, 1); x59 -= l.x * x4; x59 -= l.y * x5; x59 -= l.z * x6; x59 -= l.w * x7; } { const v4f l = GDN_L4(59, 2); x59 -= l.x * x8; x59 -= l.y * x9; x59 -= l.z * x10; x59 -= l.w * x11; } { const v4f l = GDN_L4(59, 3); x59 -= l.x * x12; x59 -= l.y * x13; x59 -= l.z * x14; x59 -= l.w * x15; } { const v4f l = GDN_L4(59, 4); x59 -= l.x * x16; x59 -= l.y * x17; x59 -= l.z * x18; x59 -= l.w * x19; } { const v4f l = GDN_L4(59, 5); x59 -= l.x * x20; x59 -= l.y * x21; x59 -= l.z * x22; x59 -= l.w * x23; } { const v4f l = GDN_L4(59, 6); x59 -= l.x * x24; x59 -= l.y * x25; x59 -= l.z * x26; x59 -= l.w * x27; } { const v4f l = GDN_L4(59, 7); x59 -= l.x * x28; x59 -= l.y * x29; x59 -= l.z * x30; x59 -= l.w * x31; } { const v4f l = GDN_L4(59, 8); x59 -= l.x * x32; x59 -= l.y * x33; x59 -= l.z * x34; x59 -= l.w * x35; } { const v4f l = GDN_L4(59, 9); x59 -= l.x * x36; x59 -= l.y * x37; x59 -= l.z * x38; x59 -= l.w * x39; } { const v4f l = GDN_L4(59, 10); x59 -= l.x * x40; x59 -= l.y * x41; x59 -= l.z * x42; x59 -= l.w * x43; } { const v4f l = GDN_L4(59, 11); x59 -= l.x * x44; x59 -= l.y * x45; x59 -= l.z * x46; x59 -= l.w * x47; } { const v4f l = GDN_L4(59, 12); x59 -= l.x * x48; x59 -= l.y * x49; x59 -= l.z * x50; x59 -= l.w * x51; } { const v4f l = GDN_L4(59, 13); x59 -= l.x * x52; x59 -= l.y * x53; x59 -= l.z * x54; x59 -= l.w * x55; } { const v4f l = GDN_L4(59, 14); x59 -= l.x * x56; x59 -= l.y * x57; x59 -= l.z * x58; } __builtin_amdgcn_sched_barrier(0);
        float x60 = GDN_RHS(60); { const v4f l = GDN_L4(60, 0); x60 -= l.x * x0; x60 -= l.y * x1; x60 -= l.z * x2; x60 -= l.w * x3; } { const v4f l = GDN_L4(60, 1); x60 -= l.x * x4; x60 -= l.y * x5; x60 -= l.z * x6; x60 -= l.w * x7; } { const v4f l = GDN_L4(60, 2); x60 -= l.x * x8; x60 -= l.y * x9; x60 -= l.z * x10; x60 -= l.w * x11; } { const v4f l = GDN_L4(60, 3); x60 -= l.x * x12; x60 -= l.y * x13; x60 -= l.z * x14; x60 -= l.w * x15; } { const v4f l = GDN_L4(60, 4); x60 -= l.x * x16; x60 -= l.y * x17; x60 -= l.z * x18; x60 -= l.w * x19; } { const v4f l = GDN_L4(60, 5); x60 -= l.x * x20; x60 -= l.y * x21; x60 -= l.z * x22; x60 -= l.w * x23; } { const v4f l = GDN_L4(60, 6); x60 -= l.x * x24; x60 -= l.y * x25; x60 -= l.z * x26; x60 -= l.w * x27; } { const v4f l = GDN_L4(60, 7); x60 -= l.x * x28; x60 -= l.y * x29; x60 -= l.z * x30; x60 -= l.w * x31; } { const v4f l = GDN_L4(60, 8); x60 -= l.x * x32; x60 -= l.y * x33; x60 -= l.z * x34; x60 -= l.w * x35; } { const v4f l = GDN_L4(60, 9); x60 -= l.x * x36; x60 -= l.y * x37; x60 -= l.z * x38; x60 -= l.w * x39; } { const v4f l = GDN_L4(60, 10); x60 -= l.x * x40; x60 -= l.y * x41; x60 -= l.z * x42; x60 -= l.w * x43; } { const v4f l = GDN_L4(60, 11); x60 -= l.x * x44; x60 -= l.y * x45; x60 -= l.z * x46; x60 -= l.w * x47; } { const v4f l = GDN_L4(60, 12); x60 -= l.x * x48; x60 -= l.y * x49; x60 -= l.z * x50; x60 -= l.w * x51; } { const v4f l = GDN_L4(60, 13); x60 -= l.x * x52; x60 -= l.y * x53; x60 -= l.z * x54; x60 -= l.w * x55; } { const v4f l = GDN_L4(60, 14); x60 -= l.x * x56; x60 -= l.y * x57; x60 -= l.z * x58; x60 -= l.w * x59; } __builtin_amdgcn_sched_barrier(0);
        float x61 = GDN_RHS(61); { const v4f l = GDN_L4(61, 0); x61 -= l.x * x0; x61 -= l.y * x1; x61 -= l.z * x2; x61 -= l.w * x3; } { const v4f l = GDN_L4(61, 1); x61 -= l.x * x4; x61 -= l.y * x5; x61 -= l.z * x6; x61 -= l.w * x7; } { const v4f l = GDN_L4(61, 2); x61 -= l.x * x8; x61 -= l.y * x9; x61 -= l.z * x10; x61 -= l.w * x11; } { const v4f l = GDN_L4(61, 3); x61 -= l.x * x12; x61 -= l.y * x13; x61 -= l.z * x14; x61 -= l.w * x15; } { const v4f l = GDN_L4(61, 4); x61 -= l.x * x16; x61 -= l.y * x17; x61 -= l.z * x18; x61 -= l.w * x19; } { const v4f l = GDN_L4(61, 5); x61 -= l.x * x20; x61 -= l.y * x21; x61 -= l.z * x22; x61 -= l.w * x23; } { const v4f l = GDN_L4(61, 6); x61 -= l.x * x24; x61 -= l.y * x25; x61 -= l.z * x26; x61 -= l.w * x27; } { const v4f l = GDN_L4(61, 7); x61 -= l.x * x28; x61 -= l.y * x29; x61 -= l.z * x30; x61 -= l.w * x31; } { const v4f l = GDN_L4(61, 8); x61 -= l.x * x32; x61 -= l.y * x33; x61 -= l.z * x34; x61 -= l.w * x35; } { const v4f l = GDN_L4(61, 9); x61 -= l.x * x36; x61 -= l.y * x37; x61 -= l.z * x38; x61 -= l.w * x39; } { const v4f l = GDN_L4(61, 10); x61 -= l.x * x40; x61 -= l.y * x41; x61 -= l.z * x42; x61 -= l.w * x43; } { const v4f l = GDN_L4(61, 11); x61 -= l.x * x44; x61 -= l.y * x45; x61 -= l.z * x46; x61 -= l.w * x47; } { const v4f l = GDN_L4(61, 12); x61 -= l.x * x48; x61 -= l.y * x49; x61 -= l.z * x50; x61 -= l.w * x51; } { const v4f l = GDN_L4(61, 13); x61 -= l.x * x52; x61 -= l.y * x53; x61 -= l.z * x54; x61 -= l.w * x55; } { const v4f l = GDN_L4(61, 14); x61 -= l.x * x56; x61 -= l.y * x57; x61 -= l.z * x58; x61 -= l.w * x59; } { const v4f l = GDN_L4(61, 15); x61 -= l.x * x60; } __builtin_amdgcn_sched_barrier(0);
        float x62 = GDN_RHS(62); { const v4f l = GDN_L4(62, 0); x62 -= l.x * x0; x62 -= l.y * x1; x62 -= l.z * x2; x62 -= l.w * x3; } { const v4f l = GDN_L4(62, 1); x62 -= l.x * x4; x62 -= l.y * x5; x62 -= l.z * x6; x62 -= l.w * x7; } { const v4f l = GDN_L4(62, 2); x62 -= l.x * x8; x62 -= l.y * x9; x62 -= l.z * x10; x62 -= l.w * x11; } { const v4f l = GDN_L4(62, 3); x62 -= l.x * x12; x62 -= l.y * x13; x62 -= l.z * x14; x62 -= l.w * x15; } { const v4f l = GDN_L4(62, 4); x62 -= l.x * x16; x62 -= l.y * x17; x62 -= l.z * x18; x62 -= l.w * x19; } { const v4f l = GDN_L4(62, 5); x62 -= l.x * x20; x62 -= l.y * x21; x62 -= l.z * x22; x62 -= l.w * x23; } { const v4f l = GDN_L4(62, 6); x62 -= l.x * x24; x62 -= l.y * x25; x62 -= l.z * x26; x62 -= l.w * x27; } { const v4f l = GDN_L4(62, 7); x62 -= l.x * x28; x62 -= l.y * x29; x62 -= l.z * x30; x62 -= l.w * x31; } { const v4f l = GDN_L4(62, 8); x62 -= l.x * x32; x62 -= l.y * x33; x62 -= l.z * x34; x62 -= l.w * x35; } { const v4f l = GDN_L4(62, 9); x62 -= l.x * x36; x62 -= l.y * x37; x62 -= l.z * x38; x62 -= l.w * x39; } { const v4f l = GDN_L4(62, 10); x62 -= l.x * x40; x62 -= l.y * x41; x62 -= l.z * x42; x62 -= l.w * x43; } { const v4f l = GDN_L4(62, 11); x62 -= l.x * x44; x62 -= l.y * x45; x62 -= l.z * x46; x62 -= l.w * x47; } { const v4f l = GDN_L4(62, 12); x62 -= l.x * x48; x62 -= l.y * x49; x62 -= l.z * x50; x62 -= l.w * x51; } { const v4f l = GDN_L4(62, 13); x62 -= l.x * x52; x62 -= l.y * x53; x62 -= l.z * x54; x62 -= l.w * x55; } { const v4f l = GDN_L4(62, 14); x62 -= l.x * x56; x62 -= l.y * x57; x62 -= l.z * x58; x62 -= l.w * x59; } { const v4f l = GDN_L4(62, 15); x62 -= l.x * x60; x62 -= l.y * x61; } __builtin_amdgcn_sched_barrier(0);
        float x63 = GDN_RHS(63); { const v4f l = GDN_L4(63, 0); x63 -= l.x * x0; x63 -= l.y * x1; x63 -= l.z * x2; x63 -= l.w * x3; } { const v4f l = GDN_L4(63, 1); x63 -= l.x * x4; x63 -= l.y * x5; x63 -= l.z * x6; x63 -= l.w * x7; } { const v4f l = GDN_L4(63, 2); x63 -= l.x * x8; x63 -= l.y * x9; x63 -= l.z * x10; x63 -= l.w * x11; } { const v4f l = GDN_L4(63, 3); x63 -= l.x * x12; x63 -= l.y * x13; x63 -= l.z * x14; x63 -= l.w * x15; } { const v4f l = GDN_L4(63, 4); x63 -= l.x * x16; x63 -= l.y * x17; x63 -= l.z * x18; x63 -= l.w * x19; } { const v4f l = GDN_L4(63, 5); x63 -= l.x * x20; x63 -= l.y * x21; x63 -= l.z * x22; x63 -= l.w * x23; } { const v4f l = GDN_L4(63, 6); x63 -= l.x * x24; x63 -= l.y * x25; x63 -= l.z * x26; x63 -= l.w * x27; } { const v4f l = GDN_L4(63, 7); x63 -= l.x * x28; x63 -= l.y * x29; x63 -= l.z * x30; x63 -= l.w * x31; } { const v4f l = GDN_L4(63, 8); x63 -= l.x * x32; x63 -= l.y * x33; x63 -= l.z * x34; x63 -= l.w * x35; } { const v4f l = GDN_L4(63, 9); x63 -= l.x * x36; x63 -= l.y * x37; x63 -= l.z * x38; x63 -= l.w * x39; } { const v4f l = GDN_L4(63, 10); x63 -= l.x * x40; x63 -= l.y * x41; x63 -= l.z * x42; x63 -= l.w * x43; } { const v4f l = GDN_L4(63, 11); x63 -= l.x * x44; x63 -= l.y * x45; x63 -= l.z * x46; x63 -= l.w * x47; } { const v4f l = GDN_L4(63, 12); x63 -= l.x * x48; x63 -= l.y * x49; x63 -= l.z * x50; x63 -= l.w * x51; } { const v4f l = GDN_L4(63, 13); x63 -= l.x * x52; x63 -= l.y * x53; x63 -= l.z * x54; x63 -= l.w * x55; } { const v4f l = GDN_L4(63, 14); x63 -= l.x * x56; x63 -= l.y * x57; x63 -= l.z * x58; x63 -= l.w * x59; } { const v4f l = GDN_L4(63, 15); x63 -= l.x * x60; x63 -= l.y * x61; x63 -= l.z * x62; } __builtin_amdgcn_sched_barrier(0);
        if (c < 128) { GU[0 * 128 + c] = x0; GU[1 * 128 + c] = x1; GU[2 * 128 + c] = x2; GU[3 * 128 + c] = x3; GU[4 * 128 + c] = x4; GU[5 * 128 + c] = x5; GU[6 * 128 + c] = x6; GU[7 * 128 + c] = x7; GU[8 * 128 + c] = x8; GU[9 * 128 + c] = x9; GU[10 * 128 + c] = x10; GU[11 * 128 + c] = x11; GU[12 * 128 + c] = x12; GU[13 * 128 + c] = x13; GU[14 * 128 + c] = x14; GU[15 * 128 + c] = x15; GU[16 * 128 + c] = x16; GU[17 * 128 + c] = x17; GU[18 * 128 + c] = x18; GU[19 * 128 + c] = x19; GU[20 * 128 + c] = x20; GU[21 * 128 + c] = x21; GU[22 * 128 + c] = x22; GU[23 * 128 + c] = x23; GU[24 * 128 + c] = x24; GU[25 * 128 + c] = x25; GU[26 * 128 + c] = x26; GU[27 * 128 + c] = x27; GU[28 * 128 + c] = x28; GU[29 * 128 + c] = x29; GU[30 * 128 + c] = x30; GU[31 * 128 + c] = x31; GU[32 * 128 + c] = x32; GU[33 * 128 + c] = x33; GU[34 * 128 + c] = x34; GU[35 * 128 + c] = x35; GU[36 * 128 + c] = x36; GU[37 * 128 + c] = x37; GU[38 * 128 + c] = x38; GU[39 * 128 + c] = x39; GU[40 * 128 + c] = x40; GU[41 * 128 + c] = x41; GU[42 * 128 + c] = x42; GU[43 * 128 + c] = x43; GU[44 * 128 + c] = x44; GU[45 * 128 + c] = x45; GU[46 * 128 + c] = x46; GU[47 * 128 + c] = x47; GU[48 * 128 + c] = x48; GU[49 * 128 + c] = x49; GU[50 * 128 + c] = x50; GU[51 * 128 + c] = x51; GU[52 * 128 + c] = x52; GU[53 * 128 + c] = x53; GU[54 * 128 + c] = x54; GU[55 * 128 + c] = x55; GU[56 * 128 + c] = x56; GU[57 * 128 + c] = x57; GU[58 * 128 + c] = x58; GU[59 * 128 + c] = x59; GU[60 * 128 + c] = x60; GU[61 * 128 + c] = x61; GU[62 * 128 + c] = x62; GU[63 * 128 + c] = x63; }
        else { GNW[0 * 128 + (c - 128)] = (bf16)f2bf(-x0); GNW[1 * 128 + (c - 128)] = (bf16)f2bf(-x1); GNW[2 * 128 + (c - 128)] = (bf16)f2bf(-x2); GNW[3 * 128 + (c - 128)] = (bf16)f2bf(-x3); GNW[4 * 128 + (c - 128)] = (bf16)f2bf(-x4); GNW[5 * 128 + (c - 128)] = (bf16)f2bf(-x5); GNW[6 * 128 + (c - 128)] = (bf16)f2bf(-x6); GNW[7 * 128 + (c - 128)] = (bf16)f2bf(-x7); GNW[8 * 128 + (c - 128)] = (bf16)f2bf(-x8); GNW[9 * 128 + (c - 128)] = (bf16)f2bf(-x9); GNW[10 * 128 + (c - 128)] = (bf16)f2bf(-x10); GNW[11 * 128 + (c - 128)] = (bf16)f2bf(-x11); GNW[12 * 128 + (c - 128)] = (bf16)f2bf(-x12); GNW[13 * 128 + (c - 128)] = (bf16)f2bf(-x13); GNW[14 * 128 + (c - 128)] = (bf16)f2bf(-x14); GNW[15 * 128 + (c - 128)] = (bf16)f2bf(-x15); GNW[16 * 128 + (c - 128)] = (bf16)f2bf(-x16); GNW[17 * 128 + (c - 128)] = (bf16)f2bf(-x17); GNW[18 * 128 + (c - 128)] = (bf16)f2bf(-x18); GNW[19 * 128 + (c - 128)] = (bf16)f2bf(-x19); GNW[20 * 128 + (c - 128)] = (bf16)f2bf(-x20); GNW[21 * 128 + (c - 128)] = (bf16)f2bf(-x21); GNW[22 * 128 + (c - 128)] = (bf16)f2bf(-x22); GNW[23 * 128 + (c - 128)] = (bf16)f2bf(-x23); GNW[24 * 128 + (c - 128)] = (bf16)f2bf(-x24); GNW[25 * 128 + (c - 128)] = (bf16)f2bf(-x25); GNW[26 * 128 + (c - 128)] = (bf16)f2bf(-x26); GNW[27 * 128 + (c - 128)] = (bf16)f2bf(-x27); GNW[28 * 128 + (c - 128)] = (bf16)f2bf(-x28); GNW[29 * 128 + (c - 128)] = (bf16)f2bf(-x29); GNW[30 * 128 + (c - 128)] = (bf16)f2bf(-x30); GNW[31 * 128 + (c - 128)] = (bf16)f2bf(-x31); GNW[32 * 128 + (c - 128)] = (bf16)f2bf(-x32); GNW[33 * 128 + (c - 128)] = (bf16)f2bf(-x33); GNW[34 * 128 + (c - 128)] = (bf16)f2bf(-x34); GNW[35 * 128 + (c - 128)] = (bf16)f2bf(-x35); GNW[36 * 128 + (c - 128)] = (bf16)f2bf(-x36); GNW[37 * 128 + (c - 128)] = (bf16)f2bf(-x37); GNW[38 * 128 + (c - 128)] = (bf16)f2bf(-x38); GNW[39 * 128 + (c - 128)] = (bf16)f2bf(-x39); GNW[40 * 128 + (c - 128)] = (bf16)f2bf(-x40); GNW[41 * 128 + (c - 128)] = (bf16)f2bf(-x41); GNW[42 * 128 + (c - 128)] = (bf16)f2bf(-x42); GNW[43 * 128 + (c - 128)] = (bf16)f2bf(-x43); GNW[44 * 128 + (c - 128)] = (bf16)f2bf(-x44); GNW[45 * 128 + (c - 128)] = (bf16)f2bf(-x45); GNW[46 * 128 + (c - 128)] = (bf16)f2bf(-x46); GNW[47 * 128 + (c - 128)] = (bf16)f2bf(-x47); GNW[48 * 128 + (c - 128)] = (bf16)f2bf(-x48); GNW[49 * 128 + (c - 128)] = (bf16)f2bf(-x49); GNW[50 * 128 + (c - 128)] = (bf16)f2bf(-x50); GNW[51 * 128 + (c - 128)] = (bf16)f2bf(-x51); GNW[52 * 128 + (c - 128)] = (bf16)f2bf(-x52); GNW[53 * 128 + (c - 128)] = (bf16)f2bf(-x53); GNW[54 * 128 + (c - 128)] = (bf16)f2bf(-x54); GNW[55 * 128 + (c - 128)] = (bf16)f2bf(-x55); GNW[56 * 128 + (c - 128)] = (bf16)f2bf(-x56); GNW[57 * 128 + (c - 128)] = (bf16)f2bf(-x57); GNW[58 * 128 + (c - 128)] = (bf16)f2bf(-x58); GNW[59 * 128 + (c - 128)] = (bf16)f2bf(-x59); GNW[60 * 128 + (c - 128)] = (bf16)f2bf(-x60); GNW[61 * 128 + (c - 128)] = (bf16)f2bf(-x61); GNW[62 * 128 + (c - 128)] = (bf16)f2bf(-x62); GNW[63 * 128 + (c - 128)] = (bf16)f2bf(-x63); }
#undef GDN_RHS
#undef GDN_L4
    } else {
        const int t2 = tid - 256; const float gl = gcs[63];
        { const int i = t2 >> 2, d0 = (t2 & 3) * 32; const float e = __expf(gcs[i]);
#pragma unroll
          for (int x8 = 0; x8 < 4; ++x8) { const v4f a = *(const LAS v4f*)(qs + i * QP + d0 + 8 * x8), b = *(const LAS v4f*)(qs + i * QP + d0 + 8 * x8 + 4);
              v4u w; w.x = pk2(a.x * e, a.y * e); w.y = pk2(a.z * e, a.w * e); w.z = pk2(b.x * e, b.y * e); w.w = pk2(b.z * e, b.w * e); *(v4u*)(GQG + i * 128 + d0 + 8 * x8) = w; } }
        { const int d = t2 >> 1, j0 = (t2 & 1) * 32;
#pragma unroll
          for (int x8 = 0; x8 < 4; ++x8) { float o[8];
#pragma unroll
              for (int x = 0; x < 8; ++x) { const int j = j0 + 8 * x8 + x; o[x] = ks[j * QP + d] * __expf(gl - gcs[j]); }
              v4u w; w.x = pk2(o[0], o[1]); w.y = pk2(o[2], o[3]); w.z = pk2(o[4], o[5]); w.w = pk2(o[6], o[7]); *(v4u*)(GKT + d * 64 + j0 + 8 * x8) = w; } }
        if (t2 == 0) GDL[item] = __expf(gl);
    }
    __syncthreads();
}
struct GdnFrags { bf16x8_t nw[4], qg[4], at[2], kt[2][2]; float u[4]; float dl; };
__device__ __forceinline__ void gdn_load(GdnFrags& F, const Params& p, int item, int off128, int off64, int offk, int offu) {
    const bf16* GNW = (const bf16*)(p.ws + WS_GNW) + (size_t)item * 8192; const bf16* GQG = (const bf16*)(p.ws + WS_GQG) + (size_t)item * 8192;
    const bf16* GAT = (const bf16*)(p.ws + WS_GAT) + (size_t)item * 4096; const bf16* GKT = (const bf16*)(p.ws + WS_GKT) + (size_t)item * 8192; const float* GU = (const float*)(p.ws + WS_GU) + (size_t)item * 8192;
#pragma unroll
    for (int ks = 0; ks < 4; ++ks) { F.nw[ks] = *(const bf16x8_t*)(GNW + off128 + 32 * ks); F.qg[ks] = *(const bf16x8_t*)(GQG + off128 + 32 * ks); }
#pragma unroll
    for (int ks = 0; ks < 2; ++ks) { F.at[ks] = *(const bf16x8_t*)(GAT + off64 + 32 * ks); F.kt[0][ks] = *(const bf16x8_t*)(GKT + offk + 32 * ks); F.kt[1][ks] = *(const bf16x8_t*)(GKT + offk + 1024 + 32 * ks); }
#pragma unroll
    for (int r = 0; r < 4; ++r) F.u[r] = GU[offu + r * 128];
    F.dl = ((const float*)(p.ws + WS_GDL))[item];
}
constexpr int STP = 136, VNP = 72;
__device__ __forceinline__ void gdn_seq(const Params& p, LAS unsigned char* lds, int wgi, int wave, int lane) {
    const int u = wgi * 2 + (wave >> 2), wi = wave & 3, h = u >> 3, sl = u & 7, g = lane >> 4, c = lane & 15;
    LAS unsigned short* ST = (LAS unsigned short*)(lds + (wave >> 2) * 12288);
    LAS unsigned short* VNT = ST + 2 * 16 * STP;
    float* GO = (float*)(p.ws + WS_GO);
    const int off128 = (16 * wi + c) * 128 + 8 * g, off64 = (16 * wi + c) * 64 + 8 * g, offk = (32 * wi + c) * 64 + 8 * g, offu = (16 * wi + 4 * g) * 128 + 16 * sl + c;
#pragma unroll
    for (int mt = 0; mt < 2; ++mt) *(LAS v2u*)(ST + c * STP + 16 * (2 * wi + mt) + 4 * g) = (v2u){0u, 0u};
    pg8::f32x4 Sacc[2] = {{0.f, 0.f, 0.f, 0.f}, {0.f, 0.f, 0.f, 0.f}};
    __syncthreads();
    GdnFrags F0, F1;
    gdn_load(F0, p, h, off128, off64, offk, offu);
#define GDN_STEP(F, n_) do { const int cur = (n_) & 1; bf16x8_t sf[4]; \
        _Pragma("unroll") for (int ks = 0; ks < 4; ++ks) sf[ks] = *(const LAS bf16x8_t*)(ST + cur * 16 * STP + c * STP + 32 * ks + 8 * g); \
        pg8::f32x4 vn = {F.u[0], F.u[1], F.u[2], F.u[3]}; \
        _Pragma("unroll") for (int ks = 0; ks < 4; ++ks) vn = __builtin_amdgcn_mfma_f32_16x16x32_bf16(F.nw[ks], sf[ks], vn, 0, 0, 0); \
        { v2u w; w.x = pk2(vn[0], vn[1]); w.y = pk2(vn[2], vn[3]); *(LAS v2u*)(VNT + c * VNP + 16 * wi + 4 * g) = w; } \
        LDS_BAR(); \
        const bf16x8_t v0 = *(const LAS bf16x8_t*)(VNT + c * VNP + 8 * g), v1 = *(const LAS bf16x8_t*)(VNT + c * VNP + 32 + 8 * g); \
        pg8::f32x4 o = {0.f, 0.f, 0.f, 0.f}; \
        _Pragma("unroll") for (int ks = 0; ks < 4; ++ks) o = __builtin_amdgcn_mfma_f32_16x16x32_bf16(F.qg[ks], sf[ks], o, 0, 0, 0); \
        o = __builtin_amdgcn_mfma_f32_16x16x32_bf16(F.at[0], v0, o, 0, 0, 0); o = __builtin_amdgcn_mfma_f32_16x16x32_bf16(F.at[1], v1, o, 0, 0, 0); \
        { const size_t tb = (size_t)(n_) * 64 + 16 * wi + 4 * g; _Pragma("unroll") for (int r = 0; r < 4; ++r) GO[(tb + r) * BW + h * 128 + 16 * sl + c] = o[r]; } \
        _Pragma("unroll") for (int mt = 0; mt < 2; ++mt) { Sacc[mt] = Sacc[mt] * F.dl; \
            Sacc[mt] = __builtin_amdgcn_mfma_f32_16x16x32_bf16(F.kt[mt][0], v0, Sacc[mt], 0, 0, 0); Sacc[mt] = __builtin_amdgcn_mfma_f32_16x16x32_bf16(F.kt[mt][1], v1, Sacc[mt], 0, 0, 0); \
            v2u w; w.x = pk2(Sacc[mt][0], Sacc[mt][1]); w.y = pk2(Sacc[mt][2], Sacc[mt][3]); *(LAS v2u*)(ST + (cur ^ 1) * 16 * STP + c * STP + 16 * (2 * wi + mt) + 4 * g) = w; } \
        LDS_BAR(); } while (0)
    for (int n = 0; n < T / 64; n += 2) {
        gdn_load(F1, p, (n + 1) * 4 + h, off128, off64, offk, offu);
        GDN_STEP(F0, n);
        gdn_load(F0, p, ((n + 2 < T / 64) ? n + 2 : n) * 4 + h, off128, off64, offk, offu);
        GDN_STEP(F1, n + 1);
    }
#undef GDN_STEP
}

constexpr int SEQ_UOFF = 132096;
constexpr int GI_NW = 0, GI_QG = 8704, GI_AT = 17408, GI_KT = 22016, GI_SZ = 31232;
struct GdnStage { v4u r[7]; float u[4]; float dl; };
__device__ __forceinline__ void gdn_stage_load(GdnStage& Sg, const Params& p, int item, int tid, int offu) {
    const bf16* GNW = (const bf16*)(p.ws + WS_GNW) + (size_t)item * 8192; const bf16* GQG = (const bf16*)(p.ws + WS_GQG) + (size_t)item * 8192;
    const bf16* GAT = (const bf16*)(p.ws + WS_GAT) + (size_t)item * 4096; const bf16* GKT = (const bf16*)(p.ws + WS_GKT) + (size_t)item * 8192; const float* GU = (const float*)(p.ws + WS_GU) + (size_t)item * 8192;
    Sg.r[0] = *(const v4u*)(GNW + 8 * tid); Sg.r[1] = *(const v4u*)(GNW + 8 * (tid + 512)); Sg.r[2] = *(const v4u*)(GQG + 8 * tid); Sg.r[3] = *(const v4u*)(GQG + 8 * (tid + 512));
    Sg.r[4] = *(const v4u*)(GAT + 8 * tid); Sg.r[5] = *(const v4u*)(GKT + 8 * tid); Sg.r[6] = *(const v4u*)(GKT + 8 * (tid + 512));
#pragma unroll
    for (int r = 0; r < 4; ++r) Sg.u[r] = GU[offu + r * 128];
    Sg.dl = ((const float*)(p.ws + WS_GDL))[item];
}
__device__ __forceinline__ void gdn_stage_write(const GdnStage& Sg, LAS unsigned short* img, int tid) {
    { const int p0 = tid, p1 = tid + 512;
      *(LAS v4u*)(img + GI_NW + (p0 >> 4) * 136 + 8 * (p0 & 15)) = Sg.r[0]; *(LAS v4u*)(img + GI_NW + (p1 >> 4) * 136 + 8 * (p1 & 15)) = Sg.r[1];
      *(LAS v4u*)(img + GI_QG + (p0 >> 4) * 136 + 8 * (p0 & 15)) = Sg.r[2]; *(LAS v4u*)(img + GI_QG + (p1 >> 4) * 136 + 8 * (p1 & 15)) = Sg.r[3];
      *(LAS v4u*)(img + GI_AT + (p0 >> 3) * 72 + 8 * (p0 & 7)) = Sg.r[4];
      *(LAS v4u*)(img + GI_KT + (p0 >> 3) * 72 + 8 * (p0 & 7)) = Sg.r[5]; *(LAS v4u*)(img + GI_KT + (p1 >> 3) * 72 + 8 * (p1 & 7)) = Sg.r[6]; }
}
__device__ __forceinline__ void gdn_seq2(const Params& p, LAS unsigned char* lds, int wgi, int tid, int wave, int lane) {
    const int h = wgi >> 2, sl = 2 * (wgi & 3) + (wave >> 2), wi = wave & 3, g = lane >> 4, c = lane & 15;
    LAS unsigned short* IMG = (LAS unsigned short*)lds;
    LAS unsigned short* ST = (LAS unsigned short*)(lds + SEQ_UOFF + (wave >> 2) * 12288);
    LAS unsigned short* VNT = ST + 2 * 16 * STP;
    float* GO = (float*)(p.ws + WS_GO);
    const int offu = (16 * wi + 4 * g) * 128 + 16 * sl + c;
#pragma unroll
    for (int mt = 0; mt < 2; ++mt) *(LAS v2u*)(ST + c * STP + 16 * (2 * wi + mt) + 4 * g) = (v2u){0u, 0u};
    pg8::f32x4 Sacc[2] = {{0.f, 0.f, 0.f, 0.f}, {0.f, 0.f, 0.f, 0.f}};
    GdnStage A, B;
    gdn_stage_load(A, p, h, tid, offu); gdn_stage_write(A, IMG, tid);
    gdn_stage_load(B, p, 4 + h, tid, offu);
    LDS_BAR();
    constexpr int NCH = T / 64;
#define GDN_STEP2(X, Y, n_) do { const int cur = (n_) & 1; const LAS unsigned short* im = IMG + cur * GI_SZ; bf16x8_t sf[4]; \
        _Pragma("unroll") for (int ks = 0; ks < 4; ++ks) sf[ks] = *(const LAS bf16x8_t*)(ST + cur * 16 * STP + c * STP + 32 * ks + 8 * g); \
        pg8::f32x4 vn = {X.u[0], X.u[1], X.u[2], X.u[3]}; const float dl = X.dl; \
        _Pragma("unroll") for (int ks = 0; ks < 4; ++ks) vn = __builtin_amdgcn_mfma_f32_16x16x32_bf16(*(const LAS bf16x8_t*)(im + GI_NW + (16 * wi + c) * 136 + 32 * ks + 8 * g), sf[ks], vn, 0, 0, 0); \
        { v2u w; w.x = pk2(vn[0], vn[1]); w.y = pk2(vn[2], vn[3]); *(LAS v2u*)(VNT + c * VNP + 16 * wi + 4 * g) = w; } \
        pg8::f32x4 o = {0.f, 0.f, 0.f, 0.f}; \
        _Pragma("unroll") for (int ks = 0; ks < 4; ++ks) o = __builtin_amdgcn_mfma_f32_16x16x32_bf16(*(const LAS bf16x8_t*)(im + GI_QG + (16 * wi + c) * 136 + 32 * ks + 8 * g), sf[ks], o, 0, 0, 0); \
        LDS_BAR(); \
        gdn_stage_load(X, p, (((n_) + 2 < NCH) ? (n_) + 2 : (n_)) * 4 + h, tid, offu); \
        const bf16x8_t v0 = *(const LAS bf16x8_t*)(VNT + c * VNP + 8 * g), v1 = *(const LAS bf16x8_t*)(VNT + c * VNP + 32 + 8 * g); \
        o = __builtin_amdgcn_mfma_f32_16x16x32_bf16(*(const LAS bf16x8_t*)(im + GI_AT + (16 * wi + c) * 72 + 8 * g), v0, o, 0, 0, 0); \
        o = __builtin_amdgcn_mfma_f32_16x16x32_bf16(*(const LAS bf16x8_t*)(im + GI_AT + (16 * wi + c) * 72 + 32 + 8 * g), v1, o, 0, 0, 0); \
        { const size_t tb = (size_t)(n_) * 64 + 16 * wi + 4 * g; _Pragma("unroll") for (int r = 0; r < 4; ++r) GO[(tb + r) * BW + h * 128 + 16 * sl + c] = o[r]; } \
        _Pragma("unroll") for (int mt = 0; mt < 2; ++mt) { Sacc[mt] = Sacc[mt] * dl; \
            Sacc[mt] = __builtin_amdgcn_mfma_f32_16x16x32_bf16(*(const LAS bf16x8_t*)(im + GI_KT + (16 * (2 * wi + mt) + c) * 72 + 8 * g), v0, Sacc[mt], 0, 0, 0); \
            Sacc[mt] = __builtin_amdgcn_mfma_f32_16x16x32_bf16(*(const LAS bf16x8_t*)(im + GI_KT + (16 * (2 * wi + mt) + c) * 72 + 32 + 8 * g), v1, Sacc[mt], 0, 0, 0); \
            v2u w; w.x = pk2(Sacc[mt][0], Sacc[mt][1]); w.y = pk2(Sacc[mt][2], Sacc[mt][3]); *(LAS v2u*)(ST + (cur ^ 1) * 16 * STP + c * STP + 16 * (2 * wi + mt) + 4 * g) = w; } \
        gdn_stage_write(Y, IMG + (cur ^ 1) * GI_SZ, tid); \
        LDS_BAR(); } while (0)
    for (int n = 0; n < NCH; n += 2) { GDN_STEP2(A, B, n); GDN_STEP2(B, A, n + 1); }
#undef GDN_STEP2
}
constexpr int MI_Q = 0, MI_S = 4608, MI_K = 9216, MI_SZ = 13824;
struct MlStage { v4u r[3]; bf16x8_t vt[2]; float fl; };
__device__ __forceinline__ void ml_stage_load(MlStage& Sg, const Params& p, int item, int tid, int offV) {
    const bf16* MQ = (const bf16*)(p.ws + WS_MQ) + (size_t)item * 4096; const bf16* MS = (const bf16*)(p.ws + WS_MS) + (size_t)item * 4096; const bf16* MK = (const bf16*)(p.ws + WS_MK) + (size_t)item * 4096;
    const bf16* MV = (const bf16*)(p.ws + WS_MV) + (size_t)item * 9216;
    Sg.r[0] = *(const v4u*)(MQ + 8 * tid); Sg.r[1] = *(const v4u*)(MS + 8 * tid); Sg.r[2] = *(const v4u*)(MK + 8 * tid);
    Sg.vt[0] = *(const bf16x8_t*)(MV + offV); Sg.vt[1] = *(const bf16x8_t*)(MV + offV + 32);
    Sg.fl = ((const float*)(p.ws + WS_MFL))[item];
}
__device__ __forceinline__ void ml_stage_write(const MlStage& Sg, LAS unsigned short* img, int tid) {
    const int o = (tid >> 3) * 72 + 8 * (tid & 7);
    *(LAS v4u*)(img + MI_Q + o) = Sg.r[0]; *(LAS v4u*)(img + MI_S + o) = Sg.r[1]; *(LAS v4u*)(img + MI_K + o) = Sg.r[2];
}
__device__ __forceinline__ void ml_seq2(const Params& p, LAS unsigned char* lds, int wgi, int tid, int wave, int lane) {
    const int h = wgi / 5, sl0 = 2 * (wgi % 5) + (wave >> 2), wi = wave & 3, g = lane >> 4, c = lane & 15;
    const bool real = sl0 < 9; const int sl = real ? sl0 : 8;
    LAS unsigned short* IMG = (LAS unsigned short*)lds;
    LAS unsigned short* CT = (LAS unsigned short*)(lds + SEQ_UOFF + (wave >> 2) * 8192);
    float* HO = (float*)(p.ws + WS_HO); float* HDEN = (float*)(p.ws + WS_HDEN);
    const int offV = (16 * sl + c) * 64 + 8 * g;
    *(LAS v2u*)(CT + c * 72 + 16 * wi + 4 * g) = (v2u){0u, 0u};
    pg8::f32x4 Cacc = {0.f, 0.f, 0.f, 0.f};
    MlStage A, B;
    ml_stage_load(A, p, h, tid, offV); ml_stage_write(A, IMG, tid);
    ml_stage_load(B, p, 4 + h, tid, offV);
    LDS_BAR();
    constexpr int NCH = T / 64;
#define ML_STEP2(X, Y, n_) do { const int cur = (n_) & 1; const LAS unsigned short* im = IMG + cur * MI_SZ; const int ro = (16 * wi + c) * 72 + 8 * g; \
        const bf16x8_t c0 = *(const LAS bf16x8_t*)(CT + cur * 16 * 72 + c * 72 + 8 * g), c1 = *(const LAS bf16x8_t*)(CT + cur * 16 * 72 + c * 72 + 32 + 8 * g); \
        const bf16x8_t vt0 = X.vt[0], vt1 = X.vt[1]; const float fl = X.fl; \
        pg8::f32x4 num = {0.f, 0.f, 0.f, 0.f}; \
        num = __builtin_amdgcn_mfma_f32_16x16x32_bf16(*(const LAS bf16x8_t*)(im + MI_Q + ro), c0, num, 0, 0, 0); num = __builtin_amdgcn_mfma_f32_16x16x32_bf16(*(const LAS bf16x8_t*)(im + MI_Q + ro + 32), c1, num, 0, 0, 0); \
        num = __builtin_amdgcn_mfma_f32_16x16x32_bf16(*(const LAS bf16x8_t*)(im + MI_S + ro), vt0, num, 0, 0, 0); num = __builtin_amdgcn_mfma_f32_16x16x32_bf16(*(const LAS bf16x8_t*)(im + MI_S + ro + 32), vt1, num, 0, 0, 0); \
        Cacc = Cacc * fl; \
        Cacc = __builtin_amdgcn_mfma_f32_16x16x32_bf16(*(const LAS bf16x8_t*)(im + MI_K + ro), vt0, Cacc, 0, 0, 0); Cacc = __builtin_amdgcn_mfma_f32_16x16x32_bf16(*(const LAS bf16x8_t*)(im + MI_K + ro + 32), vt1, Cacc, 0, 0, 0); \
        ml_stage_load(X, p, (((n_) + 2 < NCH) ? (n_) + 2 : (n_)) * 4 + h, tid, offV); \
        { v2u w; w.x = pk2(Cacc[0], Cacc[1]); w.y = pk2(Cacc[2], Cacc[3]); *(LAS v2u*)(CT + (cur ^ 1) * 16 * 72 + c * 72 + 16 * wi + 4 * g) = w; } \
        { const size_t tb = (size_t)(n_) * 64 + 16 * wi + 4 * g; \
          if (sl < 8) { _Pragma("unroll") for (int r = 0; r < 4; ++r) HO[(tb + r) * BW + h * 128 + 16 * sl + c] = num[r]; } \
          else if (c == 0 && real) { _Pragma("unroll") for (int r = 0; r < 4; ++r) HDEN[(tb + r) * 4 + h] = num[r]; } } \
        ml_stage_write(Y, IMG + (cur ^ 1) * MI_SZ, tid); \
        LDS_BAR(); } while (0)
    for (int n = 0; n < NCH; n += 2) { ML_STEP2(A, B, n); ML_STEP2(B, A, n + 1); }
#undef ML_STEP2
}

__device__ __forceinline__ void mixer_gmlp_item(const Params& p, int l, LAS unsigned char* lds, int item, int tid, int wave, int lane) {
    const int chunk = item >> 2, g = item & 3; const size_t tok0 = (size_t)chunk * 128;
    const bf16* Z = (const bf16*)(p.ws + WS_Z); bf16* BR1 = (bf16*)(p.ws + WS_BR) + 1 * BW;
    const float* ng = p.in[I_GMNG] + l * BW; const float* nb = p.in[I_GMNB] + l * BW;
    const float* wsp = p.in[I_GMWS] + ((size_t)(l * 4 + g) * 128) * 128; const float* bsp = p.in[I_GMBS] + (l * 4 + g) * 128;
    LAS float* vn = (LAS float*)lds;
    for (int r = 0; r < 16; ++r) { const int tk = wave * 16 + r;
        const v4u raw = *(const v4u*)(Z + (tok0 + tk) * ZC + ZC_GMV + 8 * lane); float x[8]; unpack8(raw, x); float s = 0.f;
#pragma unroll
        for (int i = 0; i < 8; ++i) { x[i] = gelu_tanh(x[i]); s += x[i]; }
        const float mean = wave_sum(s) * (1.f / 512.f); float ss = 0.f;
#pragma unroll
        for (int i = 0; i < 8; ++i) { x[i] -= mean; ss += x[i] * x[i]; }
        const float rstd = rsqrtf(wave_sum(ss) * (1.f / 512.f) + LN_EPS);
        if ((lane >> 4) == g) { const int cl = 8 * (lane & 15);
#pragma unroll
            for (int i = 0; i < 8; ++i) vn[tk * 128 + cl + i] = x[i] * rstd * ng[8 * lane + i] + nb[8 * lane + i]; }
    }
    __syncthreads();
    const int t = tid >> 2, cq = tid & 3; float acc[32];
#pragma unroll
    for (int i = 0; i < 32; ++i) acc[i] = 0.f;
    const float* wrow = wsp + (size_t)t * 128;
    for (int s = 0; s <= t; ++s) { const float w = wrow[s]; const LAS float* row = vn + s * 128 + cq * 32;
#pragma unroll
        for (int i4 = 0; i4 < 8; ++i4) { const v4f a = *(const LAS v4f*)(row + 4 * i4); acc[4 * i4] += w * a.x; acc[4 * i4 + 1] += w * a.y; acc[4 * i4 + 2] += w * a.z; acc[4 * i4 + 3] += w * a.w; } }
    const float bias = bsp[t];
#pragma unroll
    for (int i8 = 0; i8 < 4; ++i8) { const v4u raw = *(const v4u*)(Z + (tok0 + t) * ZC + ZC_GMU + g * 128 + cq * 32 + 8 * i8); float u[8]; unpack8(raw, u); float o[8];
#pragma unroll
        for (int i = 0; i < 8; ++i) o[i] = gelu_tanh(u[i]) * (acc[8 * i8 + i] + bias);
        v4u w; w.x = pk2(o[0], o[1]); w.y = pk2(o[2], o[3]); w.z = pk2(o[4], o[5]); w.w = pk2(o[6], o[7]);
        *(v4u*)(BR1 + (tok0 + t) * BRW + g * 128 + cq * 32 + 8 * i8) = w; }
    __syncthreads();
}

__device__ __forceinline__ void vt_item(const Params& p, LAS unsigned char* lds, int item, int tid) {
    const int h = item & 3, n = item >> 2; const size_t t0 = (size_t)n * 64;
    const bf16* Z = (const bf16*)(p.ws + WS_Z); bf16* VT = (bf16*)(p.ws + WS_VT);
    LAS unsigned short* vs = (LAS unsigned short*)lds;
#pragma unroll
    for (int r = 0; r < 2; ++r) { const int idx = tid + 512 * r, tk = idx >> 4, c8 = idx & 15;
        *(LAS v4u*)(vs + tk * 136 + 8 * c8) = *(const v4u*)(Z + (t0 + tk) * ZC + ZC_SBV + h * 128 + 8 * c8); }
    __syncthreads();
    { const int d = tid >> 2, jq = tid & 3; unsigned w[8];
#pragma unroll
      for (int x = 0; x < 8; ++x) w[x] = (unsigned)vs[(16 * jq + 2 * x) * 136 + d] | ((unsigned)vs[(16 * jq + 2 * x + 1) * 136 + d] << 16);
      bf16* dst = VT + ((size_t)h * 128 + d) * T + t0 + 16 * jq;
      *(v4u*)dst = (v4u){w[0], w[1], w[2], w[3]}; *(v4u*)(dst + 8) = (v4u){w[4], w[5], w[6], w[7]}; }
    __syncthreads();
}
constexpr int KTP = 136, VTP = 72;
__device__ __forceinline__ void sb_unit(const Params& p, LAS unsigned char* lds, int unit, int tid, int wave, int lane) {
    const int h = unit >> 6, q0 = (unit & 63) * 128, g = lane >> 4, c = lane & 15; const int qrow = q0 + 16 * wave + c;
    const bf16* Z = (const bf16*)(p.ws + WS_Z); const bf16* VT = (const bf16*)(p.ws + WS_VT) + (size_t)h * 128 * T; bf16* BR0 = (bf16*)(p.ws + WS_BR);
    LAS unsigned short* Kt = (LAS unsigned short*)lds;
    LAS unsigned short* Vt = Kt + 2 * 64 * KTP;
    LAS int* flags = (LAS int*)(Vt + 2 * 128 * VTP);
    bf16x8_t qf[4];
#pragma unroll
    for (int ks = 0; ks < 4; ++ks) qf[ks] = *(const bf16x8_t*)(Z + (size_t)qrow * ZC + ZC_SBQ + h * 128 + 32 * ks + 8 * g);
    pg8::f32x4 acc[8];
#pragma unroll
    for (int dt = 0; dt < 8; ++dt) acc[dt] = (pg8::f32x4){0.f, 0.f, 0.f, 0.f};
    float racc = 0.f;
    v4u kr[2], vr[2];
    const int jt = (q0 >> 6) + 1;
#define SB_GLOAD(j_) do { _Pragma("unroll") for (int r = 0; r < 2; ++r) { const int idx = tid + 512 * r; \
        kr[r] = *(const v4u*)(Z + (size_t)(64 * (j_) + (idx >> 4)) * ZC + ZC_SBK + h * 128 + 8 * (idx & 15)); \
        vr[r] = *(const v4u*)(VT + (size_t)(idx >> 3) * T + 64 * (j_) + 8 * (idx & 7)); } } while (0)
#define SB_LWRITE(b_) do { _Pragma("unroll") for (int r = 0; r < 2; ++r) { const int idx = tid + 512 * r; \
        *(LAS v4u*)(Kt + (b_) * 64 * KTP + (idx >> 4) * KTP + 8 * (idx & 15)) = kr[r]; *(LAS v4u*)(Vt + (b_) * 128 * VTP + (idx >> 3) * VTP + 8 * (idx & 7)) = vr[r]; } } while (0)
    LDS_BAR();
    SB_GLOAD(jt); SB_LWRITE(0);
    LDS_BAR();
    for (int j = jt, it = 0; j >= 0; --j, ++it) {
        const int cur = it & 1;
        SB_GLOAD(j > 0 ? j - 1 : 0);
        const bool wdone = __all(racc > 104.f);
        if (64 * j < q0 + 16 * wave + 15 && !wdone) {
            const LAS unsigned short* Kc = Kt + cur * 64 * KTP; const LAS unsigned short* Vc = Vt + cur * 128 * VTP;
            pg8::f32x4 z[4];
#pragma unroll
            for (int s = 0; s < 4; ++s) { z[s] = (pg8::f32x4){0.f, 0.f, 0.f, 0.f};
#pragma unroll
                for (int ks = 0; ks < 4; ++ks) z[s] = __builtin_amdgcn_mfma_f32_16x16x32_bf16(*(const LAS bf16x8_t*)(Kc + (16 * s + c) * KTP + 32 * ks + 8 * g), qf[ks], z[s], 0, 0, 0); }
            float sp[4][4], t[4], xs[4]; bool mk[4][4];
#pragma unroll
            for (int s = 0; s < 4; ++s) { t[s] = 0.f;
#pragma unroll
                for (int r = 0; r < 4; ++r) { const int key = 64 * j + 16 * s + 4 * g + r; mk[s][r] = key < qrow; const float zz = z[s][r] * 0.08838834764831845f; z[s][r] = zz;
                    sp[s][r] = mk[s][r] ? softplusf_(zz) : 0.f; t[s] += sp[s][r]; } }
            float grand = 0.f, higher[4];
#pragma unroll
            for (int s = 3; s >= 0; --s) { float x = t[s]; float y = __shfl(x, lane + 16); x += (g < 3) ? y : 0.f; y = __shfl(x, lane + 32); x += (g < 2) ? y : 0.f;
                xs[s] = x - t[s];
                const float tot = __shfl(x, c); higher[s] = grand; grand += tot; }
            bf16x8_t pf[2];
#pragma unroll
            for (int s = 0; s < 4; ++s) { float a[4]; float e = 0.f;
#pragma unroll
                for (int r = 3; r >= 0; --r) { const float la = z[s][r] - sp[s][r] - (racc + higher[s] + xs[s] + e); a[r] = mk[s][r] ? __expf(la) : 0.f; e += sp[s][r]; }
                const unsigned w0 = pk2(a[0], a[1]), w1 = pk2(a[2], a[3]);
                if ((s & 1) == 0) { pf[s >> 1][0] = (short)(w0 & 0xffff); pf[s >> 1][1] = (short)(w0 >> 16); pf[s >> 1][2] = (short)(w1 & 0xffff); pf[s >> 1][3] = (short)(w1 >> 16); }
                else              { pf[s >> 1][4] = (short)(w0 & 0xffff); pf[s >> 1][5] = (short)(w0 >> 16); pf[s >> 1][6] = (short)(w1 & 0xffff); pf[s >> 1][7] = (short)(w1 >> 16); } }
            racc += grand;
#pragma unroll
            for (int dt = 0; dt < 8; ++dt)
#pragma unroll
                for (int k2 = 0; k2 < 2; ++k2) { const v2u lo = *(const LAS v2u*)(Vc + (16 * dt + c) * VTP + 32 * k2 + 4 * g), hi = *(const LAS v2u*)(Vc + (16 * dt + c) * VTP + 32 * k2 + 16 + 4 * g);
                    const v4u vv = (v4u){lo.x, lo.y, hi.x, hi.y};
                    acc[dt] = __builtin_amdgcn_mfma_f32_16x16x32_bf16(__builtin_bit_cast(bf16x8_t, vv), pf[k2], acc[dt], 0, 0, 0); }
        }
        const bool wd2 = __all(racc > 104.f);
        if (lane == 0) flags[cur * 8 + wave] = wd2 ? 1 : 0;
        SB_LWRITE(cur ^ 1);
        LDS_BAR();
        int alld = 1;
#pragma unroll
        for (int w = 0; w < 8; ++w) alld &= flags[cur * 8 + w];
        if (alld) break;
    }
#undef SB_GLOAD
#undef SB_LWRITE
#pragma unroll
    for (int dt = 0; dt < 8; ++dt) { v2u w; w.x = pk2(acc[dt][0], acc[dt][1]); w.y = pk2(acc[dt][2], acc[dt][3]); *(v2u*)(BR0 + (size_t)qrow * BRW + h * 128 + 16 * dt + 4 * g) = w; }
}

__device__ __forceinline__ void phase_mixers(const Params& p, int l, LAS unsigned char* lds, int wg, int G, int tid, int wave, int lane, const XcdBarrier& bar) {
#if defined(PROBE_SPLIT)
    if (wg < 16) gdn_seq2(p, lds, wg, tid, wave, lane); else if (wg < 36) ml_seq2(p, lds, wg - 16, tid, wave, lane);
    xcd_barrier(bar);
    const int w2 = wg, G2 = G;
#else
    if (wg < 16) { gdn_seq2(p, lds, wg, tid, wave, lane); return; }
    if (wg < 36) { ml_seq2(p, lds, wg - 16, tid, wave, lane); return; }
    const int w2 = wg - 36, G2 = G - 36;
#endif
    for (int it = w2; it < 256; it += G2) mixer_gmlp_item(p, l, lds, it, tid, wave, lane);
    for (int it = w2; it < 256; it += G2) sb_unit(p, lds, it, tid, wave, lane);
#if !defined(PROBE_CONV0)
    __syncthreads();
    phase_convert<1>(p, l, lds, w2 * 8 + wave, G2 * 8, wave, lane);
#endif
}

__device__ __forceinline__ void phase_post(const Params& p, int l, int gw, int NGW, int lane) {
    const bf16* Z = (const bf16*)(p.ws + WS_Z); const float* GO = (const float*)(p.ws + WS_GO); const float* HO = (const float*)(p.ws + WS_HO); const float* HDEN = (const float*)(p.ws + WS_HDEN);
    bf16* BR2 = (bf16*)(p.ws + WS_BR) + 2 * BW; bf16* BR3 = (bf16*)(p.ws + WS_BR) + 3 * BW;
    const float* gng = p.in[I_GDNNG] + l * 128; const float* mng = p.in[I_MLNG] + l * BW;
    for (int t = gw; t < T; t += NGW) {
        {   const v4f a0 = *(const v4f*)(GO + (size_t)t * BW + 8 * lane), a1 = *(const v4f*)(GO + (size_t)t * BW + 8 * lane + 4); float o[8] = {a0.x, a0.y, a0.z, a0.w, a1.x, a1.y, a1.z, a1.w}; float ss = 0.f;
#pragma unroll
            for (int i = 0; i < 8; ++i) ss += o[i] * o[i];
            const float r = rsqrtf(sum16(ss) * (1.f / 128.f) + LN_EPS);
            const v4u graw = *(const v4u*)(Z + (size_t)t * ZC + ZC_GDNG + 8 * lane); float gt[8]; unpack8(graw, gt);
#pragma unroll
            for (int i = 0; i < 8; ++i) o[i] = o[i] * r * gng[(8 * lane + i) & 127] * siluf_(gt[i]);
            v4u w; w.x = pk2(o[0], o[1]); w.y = pk2(o[2], o[3]); w.z = pk2(o[4], o[5]); w.w = pk2(o[6], o[7]); *(v4u*)(BR2 + (size_t)t * BRW + 8 * lane) = w; }
        {   const v4f a0 = *(const v4f*)(HO + (size_t)t * BW + 8 * lane), a1 = *(const v4f*)(HO + (size_t)t * BW + 8 * lane + 4); float o[8] = {a0.x, a0.y, a0.z, a0.w, a1.x, a1.y, a1.z, a1.w}; float ss = 0.f;
            const float dn = 1.f / fmaxf(fabsf(HDEN[(size_t)t * 4 + (lane >> 4)]), 1.f);
#pragma unroll
            for (int i = 0; i < 8; ++i) { o[i] *= dn; ss += o[i] * o[i]; }
            const float r = rsqrtf(sum16(ss) * (1.f / 128.f) + LN_EPS);
            const v4u graw = *(const v4u*)(Z + (size_t)t * ZC + ZC_MLO + 8 * lane); float gt[8]; unpack8(graw, gt);
#pragma unroll
            for (int i = 0; i < 8; ++i) o[i] = o[i] * r * mng[8 * lane + i] * sigmoidf_(gt[i]);
            v4u w; w.x = pk2(o[0], o[1]); w.y = pk2(o[2], o[3]); w.z = pk2(o[4], o[5]); w.w = pk2(o[6], o[7]); *(v4u*)(BR3 + (size_t)t * BRW + 8 * lane) = w; }
    }
}

__device__ __forceinline__ void ln_row(const float* yrow, const float* g, const float* b, int lane, v4f (&v)[8]) {
    const v4f* yr = (const v4f*)yrow + lane; float s = 0.f;
#pragma unroll
    for (int j = 0; j < 8; ++j) { v[j] = yr[64 * j]; s += (v[j].x + v[j].y) + (v[j].z + v[j].w); }
    const float mean = wave_sum(s) * (1.f / D); float s2 = 0.f;
#pragma unroll
    for (int j = 0; j < 8; ++j) { v[j] = v[j] - mean; s2 += (v[j].x * v[j].x + v[j].y * v[j].y) + (v[j].z * v[j].z + v[j].w * v[j].w); }
    const float rstd = rsqrtf(wave_sum(s2) * (1.f / D) + LN_EPS);
#pragma unroll
    for (int j = 0; j < 8; ++j) { const v4f gg = ((const v4f*)g)[lane + 64 * j], bb = ((const v4f*)b)[lane + 64 * j]; v[j] = v[j] * rstd * gg + bb; }
}
__device__ __forceinline__ void phase_ln1_router(const Params& p, int l, LAS unsigned char* lds, int wg, int G, int wave, int lane, int cnt_shift = 0) {
    const float* Y = (const float*)(p.ws + WS_Y); float* X1 = (float*)(p.ws + WS_X1); bf16* X1B = (bf16*)(p.ws + WS_X1B); int* LIST = (int*)(p.ws + WS_LIST); float* WL = (float*)(p.ws + WS_WL); unsigned* SLOT = (unsigned*)(p.ws + WS_SLOT);
    unsigned* cnt = (unsigned*)(p.ws + WS_CTL) + CW_CNT + l * 4096 + cnt_shift;
    const float* g1 = p.in[I_LN1G] + (size_t)l * D; const float* b1 = p.in[I_LN1B] + (size_t)l * D;
    const float* wr = p.in[I_WR] + (size_t)l * D * NE; const float rbias = p.in[I_RB][l * NE + lane];
    LAS float* xt = (LAS float*)lds;
    LAS float* part = (LAS float*)(lds + 65536);
    LAS unsigned* selm = (LAS unsigned*)(lds + 65536 + 16384);
    LAS float* wtm = (LAS float*)(lds + 65536 + 16384 + 16640);
    LAS unsigned char* rkm = (LAS unsigned char*)(lds + 65536 + 16384 + 16640 + 16384);
    for (int tl = wg; tl < T / 8; tl += G) {
        const size_t m = (size_t)tl * 8 + wave;
        {   v4f v[8]; ln_row(Y + m * D, g1, b1, lane, v);
            v4f* xo = (v4f*)(X1 + m * D) + lane; v2u* xb = (v2u*)(X1B + m * D) + lane;
#pragma unroll
            for (int j = 0; j < 8; ++j) { xo[64 * j] = v[j];
#if MOE_UP_FP8
                { unsigned w = 0; w = __builtin_amdgcn_cvt_pk_fp8_f32(v[j].x, v[j].y, w, false); w = __builtin_amdgcn_cvt_pk_fp8_f32(v[j].z, v[j].w, w, true); ((unsigned*)((unsigned char*)X1B + m * D))[lane + 64 * j] = w; }
#else
                { v2u o; o.x = pk2(v[j].x, v[j].y); o.y = pk2(v[j].z, v[j].w); xb[64 * j] = o; }
#endif
                *(LAS v4f*)(xt + wave * D + 4 * lane + 256 * j) = v[j]; } }
        __syncthreads();
        {   float acc[8];
#pragma unroll
            for (int r = 0; r < 8; ++r) acc[r] = 0.f;
#pragma unroll 8
            for (int d4 = 0; d4 < 64; ++d4) { const int d = wave * 256 + 4 * d4;
                const float w0 = wr[(size_t)(d + 0) * NE + lane], w1 = wr[(size_t)(d + 1) * NE + lane], w2 = wr[(size_t)(d + 2) * NE + lane], w3 = wr[(size_t)(d + 3) * NE + lane];
#pragma unroll
                for (int r = 0; r < 8; ++r) { const v4f xv = *(const LAS v4f*)(xt + r * D + d); acc[r] += xv.x * w0 + xv.y * w1 + xv.z * w2 + xv.w * w3; } }
#pragma unroll
            for (int r = 0; r < 8; ++r) part[(wave * 8 + r) * 64 + lane] = acc[r]; }
        __syncthreads();
        {   float logit = 0.f;
#pragma unroll
            for (int w = 0; w < 8; ++w) logit += part[(w * 8 + wave) * 64 + lane];
            const float s = sigmoidf_(logit), biased = s + rbias;
            const float m1 = max8(biased); const float li = (float)(lane & 7);
            const float first = min8(biased == m1 ? li : 8.f);
            const float m2 = max8(li == first ? -INFINITY : biased);
            const float gs = m1 + m2; const int myg = lane >> 3; int grank = 0;
#pragma unroll
            for (int g2 = 0; g2 < 8; ++g2) { const float o = __builtin_bit_cast(float, __builtin_amdgcn_readlane(__builtin_bit_cast(int, gs), g2 * 8)); grank += (o > gs || (o == gs && g2 < myg)) ? 1 : 0; }
            const float masked = grank < 4 ? biased : -INFINITY; int rank = 0;
#pragma unroll
            for (int e2 = 0; e2 < 64; ++e2) { const float o = __builtin_bit_cast(float, __builtin_amdgcn_readlane(__builtin_bit_cast(int, masked), e2)); rank += (o > masked || (o == masked && e2 < lane)) ? 1 : 0; }
            const float wsel = rank < 6 ? s : 0.f; const float tot = wave_sum(wsel);
            const int ri = ((tl - wg) / G) * 8 + wave;
            selm[ri * 64 + lane] = (rank < 6) ? 1u : 0u; rkm[ri * 64 + lane] = (unsigned char)rank; wtm[ri * 64 + lane] = wsel / tot * 2.5f; }
        __syncthreads();
    }
    const int nrows = ((T / 8 - wg + G - 1) / G) * 8;
    if (wave == 0) { unsigned n = 0;
        for (int r = 0; r < nrows; ++r) n += selm[r * 64 + lane];
        unsigned base = 0; if (n && !(PROBE_NOATOM && cnt_shift)) base = __hip_atomic_fetch_add(cnt + 64 * lane, n, __ATOMIC_RELAXED, __HIP_MEMORY_SCOPE_AGENT);
        selm[64 * 64 + lane] = base; }
    __syncthreads();
    for (int ri = wave; ri < nrows; ri += 8) { unsigned pos = selm[64 * 64 + lane];
        for (int r = 0; r < ri; ++r) pos += selm[r * 64 + lane];
        if (selm[ri * 64 + lane]) { const size_t m = (size_t)(wg + (ri >> 3) * G) * 8 + (ri & 7); const int rk = rkm[ri * 64 + lane];
            LIST[lane * T + pos] = (int)m; WL[lane * T + pos] = wtm[ri * 64 + lane]; SLOT[m * 8 + rk] = ((unsigned)lane << 16) | pos; } }
    __syncthreads();
}
__device__ __forceinline__ void phase_combine_ln2(const Params& p, int l, float* dst, int gw, int NGW, int lane) {
    const float* X1 = (const float*)(p.ws + WS_X1); const bf16* YE = (const bf16*)(p.ws + WS_YEXP); const unsigned* SLOT = (const unsigned*)(p.ws + WS_SLOT);
    const unsigned* cnt = (const unsigned*)(p.ws + WS_CTL) + CW_CNT + l * 4096;
    const float* g2 = p.in[I_LN2G] + (size_t)l * D; const float* b2 = p.in[I_LN2B] + (size_t)l * D;
    const int tiles = ((int)cnt[64 * lane] + 255) >> 8; const float incl = wave_scan_incl((float)tiles);
    const int toff = (int)incl - tiles;
    const int tsh = __builtin_amdgcn_readlane((int)incl, 63);
    for (int m = gw; m < T; m += NGW) {
        v4f v[8]; const v4f* xr = (const v4f*)(X1 + (size_t)m * D) + lane;
#pragma unroll
        for (int j = 0; j < 8; ++j) v[j] = xr[64 * j] * ALPHA;
#pragma unroll
        for (int k = 0; k < 7; ++k) { size_t row;
            if (k == 0) row = (size_t)tsh * 256 + m;
            else { const unsigned s = __builtin_amdgcn_readfirstlane(SLOT[(size_t)m * 8 + (k - 1)]); const int e = (int)(s >> 16); row = (size_t)__builtin_amdgcn_readlane(toff, e) * 256 + (s & 0xffffu); }
            const v2u* yr = (const v2u*)(YE + row * D) + lane;
#pragma unroll
            for (int j = 0; j < 8; ++j) { const v2u y = yr[64 * j]; v[j].x += bflo(y.x); v[j].y += bfhi(y.x); v[j].z += bflo(y.y); v[j].w += bfhi(y.y); } }
        float s = 0.f;
#pragma unroll
        for (int j = 0; j < 8; ++j) s += (v[j].x + v[j].y) + (v[j].z + v[j].w);
        const float mean = wave_sum(s) * (1.f / D); float s2 = 0.f;
#pragma unroll
        for (int j = 0; j < 8; ++j) { v[j] = v[j] - mean; s2 += (v[j].x * v[j].x + v[j].y * v[j].y) + (v[j].z * v[j].z + v[j].w * v[j].w); }
        const float rstd = rsqrtf(wave_sum(s2) * (1.f / D) + LN_EPS);
        v4f* xo = (v4f*)(dst + (size_t)m * D) + lane;
#pragma unroll
        for (int j = 0; j < 8; ++j) { const v4f gg = ((const v4f*)g2)[lane + 64 * j], bb = ((const v4f*)b2)[lane + 64 * j]; xo[64 * j] = v[j] * rstd * gg + bb; }
    }
}

constexpr int NPH = 11;
template <class S> struct DupOrder {
    S s; int n;
    __device__ __forceinline__ bool next(int i, Unit& u) const { return s.next(i >= n ? i - n : i, u); }
    __device__ __forceinline__ int row_token(int i, int r) const { return s.row_token(i >= n ? i - n : i, r); }
    __device__ __forceinline__ void a_ready(const Unit& u) const { s.a_ready(u); }
    __device__ __forceinline__ void done(const Unit& u) const { s.done(u); }
};
template <class S> __device__ __forceinline__ int count_units(const S& s) { Unit u; int n = 0; while (n < 64 && s.next(n, u)) ++n; return n; }
#define ORDER_T(k, T) typename std::conditional<PROBE_DUP == (k), DupOrder<T>, T>::type
template <class S> __device__ __forceinline__ DupOrder<S> make_order(const S& s, std::true_type) { DupOrder<S> d{s, count_units(s)}; d.n = count_units(s); return d; }
template <class S> __device__ __forceinline__ S make_order(const S& s, std::false_type) { return s; }
#define MAKE_ORDER(k, s) make_order(s, std::integral_constant<bool, PROBE_DUP == (k)>())
template <int l>
__device__ __forceinline__ void run_layer(const Params& p, LAS unsigned char* lds, const XcdBarrier& bar, int tid, int lane, int wave, int G, int wg, int gw, int NGW) {
    unsigned char* ws = p.ws;
    {
        const float* xin = (l == 0) ? p.in[I_X] : (const float*)(ws + WS_XCUR);
        float* xout = (l == NL - 1) ? p.out : (float*)(ws + WS_XCUR);
#ifndef PROBE_DUP
#define PROBE_DUP (-1)
#endif
#define IS_GEMM_PH(k) ((k) == 1 || (k) == 5 || (k) == 6 || (k) == 8 || (k) == 9)
#define REP(k) _Pragma("nounroll") for (int _r = 0; _r < ((PROBE_DUP == (k) && !IS_GEMM_PH(k)) ? 2 + (p.ph_lo >> 20) : 1); ++_r)
#ifndef PH_MASK
#define PH_MASK 0x7ff
#endif
#define RUN(k) (((PH_MASK >> (k)) & 1) && p.ph_lo <= l * NPH + (k) && l * NPH + (k) < p.ph_hi)
#define SEAM(k) do { if (l * NPH + (k) + 1 < p.ph_hi) xcd_barrier(bar); } while (0)
        if (RUN(0)) { REP(0) { phase_convert<0>(p, l, lds, gw, NGW, wave, lane);
#if defined(PROBE_CONV0)
            phase_convert<1>(p, l, lds, gw, NGW, wave, lane);
#endif
 phase_xprep(p, l, xin, lds, gw, NGW, tid, lane); } SEAM(0); }
        if (RUN(1)) { REP(1) { pg8::Gemm g{(const bf16*)(ws + WS_XB), (const bf16*)(ws + WS_WIN), T, ZC, D / 2, D / 2, D / 2}; pg8::StaticOrder S; S.init(T, ZC, G, wg);
            pg8::EpiBf16<0> E{(bf16*)(ws + WS_Z), ZC, nullptr, 0, 0, 1.f / 64.f};
            auto S2 = MAKE_ORDER(1, S); pg8::gemm_phase<pg8::EpiBf16<0>, ORDER_T(1, pg8::StaticOrder), true, true, true>(lds, g, S2, E); } SEAM(1); }
        if (RUN(2)) { REP(2) { for (int it = wg; it < 1536; it += G) { if (it < 512) gdn_pre_item(p, l, lds, it, tid, wave, lane); else if (it < 1024) ml_pre_item(p, l, lds, it - 512, tid, wave, lane); else vt_item(p, lds, it - 1024, tid); } } SEAM(2); }
        if (RUN(3)) { REP(3) { phase_mixers(p, l, lds, wg, G, tid, wave, lane, bar); } SEAM(3); }
        if (RUN(4)) { REP(4) { phase_post(p, l, gw, NGW, lane); } SEAM(4); }
        if (RUN(5)) { REP(5) { pg8::Gemm g{(const bf16*)(ws + WS_BR), (const bf16*)(ws + WS_WBR), T, D, BRW, BRW, BRW}; pg8::StaticOrder S; S.init(T, D, G, wg);
            EpiMergeH E{(const bf16*)(ws + WS_Z), (bf16*)(ws + WS_MSUM)};
            auto S2 = MAKE_ORDER(5, S); pg8::gemm_phase<EpiMergeH, ORDER_T(5, pg8::StaticOrder), true, true>(lds, g, S2, E); } SEAM(5); }
        if (RUN(6)) { REP(6) { pg8::Gemm g{(const bf16*)(ws + WS_MSUM), (const bf16*)(ws + WS_WOUT), T, D, D / 2, D / 2, D / 2}; pg8::StaticOrder S; S.init(T, D, G, wg);
            EpiResid E{xin, (float*)(ws + WS_Y), 1.f / 64.f};
            auto S2 = MAKE_ORDER(6, S); pg8::gemm_phase<EpiResid, ORDER_T(6, pg8::StaticOrder), true, true, true>(lds, g, S2, E); } SEAM(6); }
        if (RUN(7)) { REP(7) { phase_ln1_router(p, l, lds, wg, G, wave, lane, (PROBE_DUP == 7 && _r == 0) ? 16384 : 0); } SEAM(7); }
        if (RUN(8)) { REP(8) { const unsigned* cnt = (const unsigned*)(ws + WS_CTL) + CW_CNT + l * 4096; MoeTab M(lds); moe_tables(M, cnt, tid, lane, wave);
            UpOrder S{M, 0}; S.n = up_order_build(M, (const int*)(ws + WS_LIST), (const float*)(ws + WS_WL), wg, G, tid);
            constexpr int KU = MOE_UP_FP8 ? D / 2 : D;
            pg8::Gemm g{(const bf16*)(ws + WS_X1B), (const bf16*)(ws + WS_WUP), T, NEX * 1024, KU, KU, KU};
            EpiGluSparse E{(LAS const float*)M.wt, (bf16*)(ws + WS_HB)};
            auto S2 = MAKE_ORDER(8, S); pg8::gemm_phase_gather<EpiGluSparse, ORDER_T(8, UpOrder), MOE_UP_FP8 != 0>(lds, g, S2, E); } SEAM(8); }
        if (RUN(9)) { REP(9) { const unsigned* cnt = (const unsigned*)(ws + WS_CTL) + CW_CNT + l * 4096; MoeTab M(lds); moe_tables(M, cnt, tid, lane, wave);
            DownOrder S{M, G, wg, 8 * M.t[65]};
            pg8::Gemm g{(const bf16*)(ws + WS_HB), (const bf16*)(ws + WS_WDN), HROWS, NEX * D, ED, ED, ED};
            EpiYexp E{(bf16*)(ws + WS_YEXP)};
            auto S2 = MAKE_ORDER(9, S); pg8::gemm_phase<EpiYexp, ORDER_T(9, DownOrder), true, true>(lds, g, S2, E); } SEAM(9); }
        if (RUN(10)) { REP(10) { phase_combine_ln2(p, l, xout, gw, NGW, lane); } SEAM(10); }
#undef RUN
#undef SEAM
    }
}
__global__ void __launch_bounds__(512, 2) fwd_kernel(Params p) {
    extern __shared__ __attribute__((aligned(16))) unsigned char lds_raw[];
    LAS unsigned char* lds = (LAS unsigned char*)lds_raw;
    const int tid = threadIdx.x, lane = tid & 63, wave = __builtin_amdgcn_readfirstlane(tid >> 6);
    const int G = gridDim.x, wg = blockIdx.x, gw = wg * 8 + wave, NGW = G * 8;
    volatile LAS unsigned* MISC = (volatile LAS unsigned*)(lds + MISC_OFF);
    if (tid < 32) MISC[tid] = 0u;
    __syncthreads();
    unsigned* ctl = (unsigned*)(p.ws + WS_CTL);
    const bool multi = (p.ph_hi - p.ph_lo) > 1;
    XcdBarrier bar; bar.bar = ctl + CW_BAR; bar.x = 0; bar.st = nullptr;
    if (multi) bar = xcd_barrier_post(ctl + CW_BAR, MISC + 8);
    run_layer<0>(p, lds, bar, tid, lane, wave, G, wg, gw, NGW);
    run_layer<1>(p, lds, bar, tid, lane, wave, G, wg, gw, NGW);
}

#ifndef MK_MULTI_LAUNCH
#define MK_MULTI_LAUNCH 0
#endif
extern "C" void kernel_launch(void* const* d_in, const int* in_sizes, int n_in, void* d_out, int out_size, void* d_ws, size_t ws_size, hipStream_t stream) {
    static int grid = 0;
    if (grid == 0) {
        if (n_in != 27 || out_size != T * D || ws_size < WS_END) { fprintf(stderr, "kernel_launch: unexpected shapes (n_in %d out %d ws %zu need %zu)\n", n_in, out_size, ws_size, (size_t)WS_END); grid = -1; return; }
        int dev = 0, cus = 0, per_cu = 0;
        if (hipGetDevice(&dev) != hipSuccess || hipDeviceGetAttribute(&cus, hipDeviceAttributeMultiprocessorCount, dev) != hipSuccess) { grid = -1; return; }
        if (hipFuncSetAttribute((const void*)fwd_kernel, hipFuncAttributeMaxDynamicSharedMemorySize, LDS_BYTES) != hipSuccess) { fprintf(stderr, "kernel_launch: hipFuncSetAttribute failed\n"); grid = -1; return; }
        if (hipOccupancyMaxActiveBlocksPerMultiprocessor(&per_cu, (const void*)fwd_kernel, 512, LDS_BYTES) != hipSuccess || per_cu < 1) { fprintf(stderr, "kernel_launch: occupancy query says %d\n", per_cu); }
        (void)hipGetLastError();
        grid = cus;
    }
    if (grid < 0) return;
    (void)hipMemsetAsync((char*)d_ws + WS_CTL, 0, CTL_ZERO_BYTES, stream);
    Params p{};
    for (int i = 0; i < 27; ++i) p.in[i] = (const float*)d_in[i];
    p.out = (float*)d_out; p.ws = (unsigned char*)d_ws;
#if MK_MULTI_LAUNCH
    for (int ph = 0; ph < NL * NPH; ++ph) { p.ph_lo = ph; p.ph_hi = ph + 1; hipLaunchKernelGGL(fwd_kernel, dim3(grid), dim3(512), LDS_BYTES, stream, p); }
#else
    p.ph_lo = 0; p.ph_hi = NL * NPH; hipLaunchKernelGGL(fwd_kernel, dim3(grid), dim3(512), LDS_BYTES, stream, p);
#endif
}
```

```cpp
#include <hip/hip_runtime.h>
#include <cstdio>
#include <cstdint>
#include <type_traits>
namespace pg8 {
#define PG8_LAS __attribute__((address_space(3)))
typedef unsigned short bf16_t;
typedef short bf16x8 __attribute__((ext_vector_type(8)));
typedef float f32x4 __attribute__((ext_vector_type(4)));
typedef unsigned u32x4 __attribute__((ext_vector_type(4)));
constexpr int BM = 256, BK = 64, HALF = 128, HTB = HALF * BK * 2  , STAGE_BYTES = 8 * HTB, NXCD = 8, WGM = 8;

__host__ __device__ __forceinline__ int lds_byte(int r, int c) { const int st = (r >> 4) * 2 + (c >> 5), rr = r & 15, cc = c & 31, ob = rr * 64 + cc * 2; return st * 1024 + (ob ^ (((ob >> 9) & 1) << 5)); }
__host__ __device__ __forceinline__ void stage_rc(int b, int& R, int& C) { const int st = b / 1024, sb = b % 1024, swz = sb ^ (((sb >> 9) & 1) << 5); R = (st >> 1) * 16 + swz / 64; C = (st & 1) * 32 + (swz % 64) / 2; }
__host__ __device__ __forceinline__ int perm32(int rho) { const int n = rho >> 4, i = rho & 15; return 8 * (i >> 2) + 4 * n + (i & 3); }

struct Unit { int pm, pn, aux; };
struct Gemm { const bf16_t* A; const bf16_t* Bt; int M, N, K, lda, ldb; };

struct StaticOrder {
    int nM, nN, nwg, G, c;
    __host__ __device__ void init(int M, int N, int G_, int c_) { nM = M / BM; nN = N / BM; nwg = nM * nN; G = G_; c = c_; }
    __host__ __device__ bool next(int i, Unit& u) const {
        const long L = (long)i * G + c; if (L >= nwg) return false;
        int wgid = (int)L; { const int q = nwg / NXCD, r = nwg % NXCD, xcd = wgid % NXCD, off = wgid / NXCD; wgid = (xcd < r ? xcd * (q + 1) : r * (q + 1) + (xcd - r) * q) + off; }
        const int nig = WGM * nN, gid = wgid / nig, fm = gid * WGM, gsz = (nM - fm) < WGM ? (nM - fm) : WGM;
        u.pm = fm + ((wgid % nig) % gsz); u.pn = (wgid % nig) / gsz; return true;
    }
    __device__ __forceinline__ void a_ready(const Unit&) const {}
    __device__ __forceinline__ void done(const Unit&) const {}
};

__device__ __forceinline__ unsigned cvt_pk_bf16(float lo, float hi) { unsigned r; asm volatile("v_cvt_pk_bf16_f32 %0, %1, %2" : "=v"(r) : "v"(lo), "v"(hi)); return r; }
typedef float f32x2 __attribute__((ext_vector_type(2)));
__device__ __forceinline__ f32x2 gelu_pk(f32x2 v) {
    const f32x2 av = __builtin_elementwise_abs(v), d = av * 0.2316418882f + 1.0f;
    f32x2 t; t.x = __builtin_amdgcn_rcpf(d.x); t.y = __builtin_amdgcn_rcpf(d.y);
    f32x2 q = t * 0.5307027145f + (-0.7265760135f); q = q * t + 0.7107068705f; q = q * t + (-0.142248368f); q = q * t + 0.127414796f; q = q * t;
    const f32x2 s = (v * v) * (-0.72134752044f);
    f32x2 e; e.x = __builtin_amdgcn_exp2f(s.x); e.y = __builtin_amdgcn_exp2f(s.y);
    const f32x2 m = v * (q * e), r = v - m;
    f32x2 o; o.x = v.x < 0.f ? m.x : r.x; o.y = v.y < 0.f ? m.y : r.y; return o;
}

template <int ACT  > struct EpiBf16 {
    static constexpr bool PERM = true, AFTER_DRAIN = false; static constexpr int MID = 0; static_assert(ACT == 0 || ACT == 1, "EpiBf16: ACT is 0 (none) or 1 (gelu_pk)");
    bf16_t* O; int ldc; const float* bias; int split_cols; size_t split_stride; float scale0;
    __device__ __forceinline__ void operator()(const f32x4 (&acc)[2][2][4][2], const Unit& u, int wr, int wc, int fr, int fq) const {
        const int row0 = u.pm * BM + wr * 64 + fr; int colt = u.pn * BM; bf16_t* base = O;
        float sc = scale0; if (split_cols) { const int t = colt / split_cols; base += (size_t)t * split_stride; colt -= t * split_cols; if (t != 0) sc = 1.f; }
        const int col0 = colt + wc * 32 + 8 * fq, bcol0 = u.pn * BM + wc * 32 + 8 * fq;
        f32x4 bv[2][2];
#pragma unroll
        for (int bj = 0; bj < 2; ++bj)
#pragma unroll
            for (int n = 0; n < 2; ++n) bv[bj][n] = bias ? *(const f32x4*)(bias + bcol0 + bj * HALF + 4 * n) : (f32x4){0.f, 0.f, 0.f, 0.f};
#pragma unroll
        for (int ai = 0; ai < 2; ++ai)
#pragma unroll
            for (int m = 0; m < 4; ++m) { bf16_t* rowp = base + (size_t)(row0 + ai * HALF + m * 16) * ldc + col0;
#pragma unroll
                for (int bj = 0; bj < 2; ++bj) { f32x4 v0 = acc[ai][bj][m][0] + bv[bj][0], v1 = acc[ai][bj][m][1] + bv[bj][1];
                    if (ACT == 1) { f32x2 a = gelu_pk((f32x2){v0[0], v0[1]}), b = gelu_pk((f32x2){v0[2], v0[3]}), c = gelu_pk((f32x2){v1[0], v1[1]}), d = gelu_pk((f32x2){v1[2], v1[3]});
                        v0 = (f32x4){a.x, a.y, b.x, b.y}; v1 = (f32x4){c.x, c.y, d.x, d.y}; }
                    v0 = v0 * sc; v1 = v1 * sc; u32x4 w; w.x = cvt_pk_bf16(v0[0], v0[1]); w.y = cvt_pk_bf16(v0[2], v0[3]); w.z = cvt_pk_bf16(v1[0], v1[1]); w.w = cvt_pk_bf16(v1[2], v1[3]);
                    *(u32x4*)(rowp + bj * HALF) = w; } }
    }
};

typedef int i32x8 __attribute__((ext_vector_type(8)));
__device__ __forceinline__ i32x8 cat8(const bf16x8 a, const bf16x8 b) { typedef int i32x4 __attribute__((ext_vector_type(4))); const i32x4 x = __builtin_bit_cast(i32x4, a), y = __builtin_bit_cast(i32x4, b); return (i32x8){x[0], x[1], x[2], x[3], y[0], y[1], y[2], y[3]}; }
__device__ __forceinline__ bf16x8 lo8(const i32x8 v) { typedef int i32x4 __attribute__((ext_vector_type(4))); return __builtin_bit_cast(bf16x8, __builtin_shufflevector(v, v, 0, 1, 2, 3)); }
__device__ __forceinline__ bf16x8 hi8(const i32x8 v) { typedef int i32x4 __attribute__((ext_vector_type(4))); return __builtin_bit_cast(bf16x8, __builtin_shufflevector(v, v, 4, 5, 6, 7)); }
template <class Epi, class Sched, bool ALIGN_EPI = false, bool SP2 = false, bool FP8 = false>
__device__ __forceinline__ void gemm_phase(PG8_LAS unsigned char* lds, const Gemm g, const Sched& S, const Epi& E) {
    const int tid = threadIdx.x, wid = __builtin_amdgcn_readfirstlane(tid >> 6), lane = tid & 63, wr = wid >> 2, wc = wid & 3, fr = lane & 15, fq = lane >> 4;
    const int K = g.K, nt = K / BK;
    unsigned voffA[2], voffB[2];
#pragma unroll
    for (int i = 0; i < 2; ++i) { int R, C; stage_rc(tid * 16 + i * 8192, R, C); const int Rb = Epi::PERM ? ((R & ~31) + perm32(R & 31)) : R;
        voffA[i] = (unsigned)(R * g.lda + C) * 2u; voffB[i] = (unsigned)(Rb * g.ldb + C) * 2u; }
    const size_t kstep = (size_t)(BK * 2);
    const size_t hstepA = (size_t)HALF * g.lda * 2, hstepB = (size_t)HALF * g.ldb * 2;
    const size_t tstepA = 2 * hstepA, tstepB = 2 * hstepB;
    const unsigned ldsw = (unsigned)wid * 1024u;
    const int aoff = lds_byte(wr * 64 + fr, fq * 8), boff = lds_byte(wc * 32 + fr, fq * 8);
#define PG8_SA(b, h) (((b) * 2 + (h)) * HTB)
#define PG8_SB(b, h) ((4 + (b) * 2 + (h)) * HTB)
#define PG8_STAGE(bufoff, gbase, voff) do { _Pragma("unroll") for (int _i = 0; _i < 2; ++_i) \
        __builtin_amdgcn_global_load_lds((const unsigned*)((const char*)(gbase) + (voff)[_i]), (PG8_LAS unsigned*)(lds + (bufoff) + ldsw + _i * 8192), 16, 0, 0); } while (0)
#define PG8_LDA(dst, b, h) do { _Pragma("unroll") for (int m = 0; m < 4; ++m) { if constexpr (FP8) dst##8[m] = cat8(*(const PG8_LAS bf16x8*)(lds + PG8_SA(b, h) + aoff + m * 2048), *(const PG8_LAS bf16x8*)(lds + PG8_SA(b, h) + aoff + m * 2048 + 1024)); \
        else { _Pragma("unroll") for (int k = 0; k < 2; ++k) dst[m][k] = *(const PG8_LAS bf16x8*)(lds + PG8_SA(b, h) + aoff + m * 2048 + k * 1024); } } } while (0)
#define PG8_LDB(dst, b, h) do { _Pragma("unroll") for (int n = 0; n < 2; ++n) { if constexpr (FP8) dst##8[n] = cat8(*(const PG8_LAS bf16x8*)(lds + PG8_SB(b, h) + boff + n * 2048), *(const PG8_LAS bf16x8*)(lds + PG8_SB(b, h) + boff + n * 2048 + 1024)); \
        else { _Pragma("unroll") for (int k = 0; k < 2; ++k) dst[n][k] = *(const PG8_LAS bf16x8*)(lds + PG8_SB(b, h) + boff + n * 2048 + k * 1024); } } } while (0)
#define PG8_MMA(ai, bj, At, Bt) do { __builtin_amdgcn_s_setprio(1); _Pragma("unroll") for (int m = 0; m < 4; ++m) _Pragma("unroll") for (int n = 0; n < 2; ++n) { \
        if constexpr (FP8) asm volatile("v_mfma_scale_f32_16x16x128_f8f6f4 %0, %1, %2, %0, %3, %3 op_sel_hi:[0,0,0]" : "+v"(acc[ai][bj][m][n]) : "v"(Bt##8[n]), "v"(At##8[m]), "v"(fp8_unit_scale)); \
        else { _Pragma("unroll") for (int k = 0; k < 2; ++k) acc[ai][bj][m][n] = __builtin_amdgcn_mfma_f32_16x16x32_bf16(Bt[n][k], At[m][k], acc[ai][bj][m][n], 0, 0, 0); } } __builtin_amdgcn_s_setprio(0); } while (0)
#define PG8_WAIT_V(n) asm volatile("s_waitcnt vmcnt(" #n ")" ::: "memory")
#define PG8_WAIT_L(n) asm volatile("s_waitcnt lgkmcnt(" #n ")" ::: "memory")
#define PG8_BAR __builtin_amdgcn_s_barrier()
#define PG8_SCHED __builtin_amdgcn_sched_barrier(0)
    Unit cur, nxt; int ui = 0;
    if (!S.next(0, cur)) return;
    f32x4 acc[2][2][4][2];
#pragma unroll
    for (int a = 0; a < 2; ++a)
#pragma unroll
        for (int b = 0; b < 2; ++b)
#pragma unroll
            for (int m = 0; m < 4; ++m)
#pragma unroll
                for (int n = 0; n < 2; ++n) acc[a][b][m][n] = (f32x4){0.f, 0.f, 0.f, 0.f};
    int fp8_unit_scale = 0x7F7F7F7F; asm volatile("" : "+v"(fp8_unit_scale));
    bf16x8 At[4][2], B0[2][2], B1[2][2];
    i32x8 At8[4], B08[2], B18[2];
    const char* cA = (const char*)g.A + (size_t)cur.pm * tstepA; const char* cB = (const char*)g.Bt + (size_t)cur.pn * tstepB;
    S.a_ready(cur);
    if constexpr (SP2) {
        PG8_STAGE(PG8_SB(0, 0), cB, voffB); PG8_STAGE(PG8_SB(0, 1), cB + hstepB, voffB); PG8_STAGE(PG8_SA(0, 0), cA, voffA); PG8_STAGE(PG8_SA(0, 1), cA + hstepA, voffA);
        if (wr == 1) PG8_BAR;
        PG8_WAIT_V(2); PG8_BAR;
        PG8_STAGE(PG8_SB(1, 0), cB + kstep, voffB); PG8_STAGE(PG8_SA(1, 0), cA + kstep, voffA); PG8_STAGE(PG8_SB(1, 1), cB + hstepB + kstep, voffB);
        PG8_WAIT_V(6); PG8_BAR;
    } else {
        PG8_STAGE(PG8_SB(0, 0), cB, voffB); PG8_STAGE(PG8_SA(0, 0), cA, voffA); PG8_STAGE(PG8_SB(0, 1), cB + hstepB, voffB); PG8_STAGE(PG8_SA(0, 1), cA + hstepA, voffA);
        if (wr == 1) PG8_BAR;
        PG8_WAIT_V(4); PG8_BAR;
        PG8_STAGE(PG8_SB(1, 0), cB + kstep, voffB); PG8_STAGE(PG8_SA(1, 0), cA + kstep, voffA); PG8_STAGE(PG8_SB(1, 1), cB + hstepB + kstep, voffB);
        PG8_WAIT_V(6); PG8_BAR;
    }
    for (;;) {
        const bool has_next = S.next(ui + 1, nxt);
        const char* nA = has_next ? (const char*)g.A + (size_t)nxt.pm * tstepA : cA; const char* nB = has_next ? (const char*)g.Bt + (size_t)nxt.pn * tstepB : cB;
        for (int t = 0; t < nt; t += 2) {
            const bool last = (t == nt - 2);
            const char* a1 = cA + (size_t)(t + 1) * kstep;
            const char* a2 = last ? nA : cA + (size_t)(t + 2) * kstep; const char* b2 = last ? nB : cB + (size_t)(t + 2) * kstep;
            const char* a3 = a2 + kstep; const char* b3 = b2 + kstep;
            if (last && has_next) S.a_ready(nxt);
            if constexpr (SP2) {
            if constexpr (Epi::MID > 0) { if (t != 0 && (t % Epi::MID) == 0) { PG8_SCHED; E.mid(acc, cur, t / Epi::MID, wr, wc, fr, fq); PG8_SCHED; } }
            PG8_LDB(B0, 0, 0); PG8_LDB(B1, 0, 1); PG8_SCHED; PG8_LDA(At, 0, 0); PG8_STAGE(PG8_SA(1, 1), a1 + hstepA, voffA);
            PG8_WAIT_V(8); PG8_WAIT_L(0); PG8_BAR; PG8_MMA(0, 0, At, B0); PG8_MMA(0, 1, At, B1); PG8_BAR; PG8_SCHED;
            PG8_LDA(At, 0, 1); PG8_STAGE(PG8_SB(0, 0), b2, voffB); PG8_STAGE(PG8_SB(0, 1), b2 + hstepB, voffB); PG8_STAGE(PG8_SA(0, 0), a2, voffA);
            PG8_WAIT_V(8); PG8_WAIT_L(0); PG8_BAR; PG8_MMA(1, 0, At, B0); PG8_MMA(1, 1, At, B1); PG8_BAR; PG8_SCHED;
            PG8_LDB(B0, 1, 0); PG8_LDB(B1, 1, 1); PG8_SCHED; PG8_LDA(At, 1, 0); PG8_STAGE(PG8_SA(0, 1), a2 + hstepA, voffA);
            PG8_WAIT_V(8); PG8_WAIT_L(0); PG8_BAR; PG8_MMA(0, 0, At, B0); PG8_MMA(0, 1, At, B1); PG8_BAR; PG8_SCHED;
            PG8_LDA(At, 1, 1); PG8_STAGE(PG8_SB(1, 0), b3, voffB); PG8_STAGE(PG8_SB(1, 1), b3 + hstepB, voffB); PG8_STAGE(PG8_SA(1, 0), a3, voffA);
            PG8_WAIT_V(8); PG8_WAIT_L(0); PG8_BAR; PG8_MMA(1, 0, At, B0); PG8_MMA(1, 1, At, B1); PG8_BAR; PG8_SCHED;
            } else {
            PG8_LDB(B0, 0, 0); PG8_SCHED; PG8_LDA(At, 0, 0); PG8_STAGE(PG8_SA(1, 1), a1 + hstepA, voffA);
            PG8_WAIT_L(8); PG8_BAR; PG8_WAIT_L(0); PG8_MMA(0, 0, At, B0); PG8_BAR; PG8_SCHED;
            PG8_LDB(B1, 0, 1); PG8_STAGE(PG8_SB(0, 0), b2, voffB);
            PG8_BAR; PG8_WAIT_L(0); PG8_MMA(0, 1, At, B1); PG8_BAR;
            PG8_LDA(At, 0, 1); PG8_STAGE(PG8_SA(0, 0), a2, voffA);
            PG8_BAR; PG8_WAIT_L(0); PG8_MMA(1, 0, At, B0); PG8_BAR; PG8_SCHED;
            PG8_STAGE(PG8_SB(0, 1), b2 + hstepB, voffB);
            PG8_WAIT_V(6); PG8_BAR; PG8_MMA(1, 1, At, B1); PG8_BAR;
            PG8_LDB(B0, 1, 0); PG8_SCHED; PG8_LDA(At, 1, 0); PG8_STAGE(PG8_SA(0, 1), a2 + hstepA, voffA);
            PG8_WAIT_L(8); PG8_BAR; PG8_WAIT_L(0); PG8_MMA(0, 0, At, B0); PG8_BAR; PG8_SCHED;
            PG8_LDB(B1, 1, 1); PG8_STAGE(PG8_SB(1, 0), b3, voffB);
            PG8_BAR; PG8_WAIT_L(0); PG8_MMA(0, 1, At, B1); PG8_BAR;
            PG8_LDA(At, 1, 1); PG8_STAGE(PG8_SA(1, 0), a3, voffA);
            PG8_BAR; PG8_WAIT_L(0); PG8_MMA(1, 0, At, B0); PG8_BAR; PG8_SCHED;
            PG8_STAGE(PG8_SB(1, 1), b3 + hstepB, voffB);
            PG8_WAIT_V(6); PG8_BAR; PG8_MMA(1, 1, At, B1); PG8_BAR;
            }
        }
        if constexpr (ALIGN_EPI) { if (wr == 0) PG8_BAR; }
        if constexpr (FP8) asm volatile("s_nop 7\n\ts_nop 7" ::: "memory");
        if constexpr (!Epi::AFTER_DRAIN) { E(acc, cur, wr, wc, fr, fq); S.done(cur); }
        if (!has_next) break;
#pragma unroll
        for (int a = 0; a < 2; ++a)
#pragma unroll
            for (int b = 0; b < 2; ++b)
#pragma unroll
                for (int m = 0; m < 4; ++m)
#pragma unroll
                    for (int n = 0; n < 2; ++n) acc[a][b][m][n] = (f32x4){0.f, 0.f, 0.f, 0.f};
        cur = nxt; cA = nA; cB = nB; ++ui;
        if constexpr (ALIGN_EPI) { if (wr == 1) PG8_BAR; }
    }
    PG8_WAIT_V(0);
    if constexpr (!ALIGN_EPI) { if (wr == 0) PG8_BAR; }
    PG8_BAR;
    if constexpr (Epi::AFTER_DRAIN) { E.fused(acc, cur, wr, wc, fr, fq, lds, wid, lane); S.done(cur); }
#undef PG8_SA
#undef PG8_SB
#undef PG8_STAGE
#undef PG8_LDA
#undef PG8_LDB
#undef PG8_MMA
#undef PG8_WAIT_V
#undef PG8_WAIT_L
#undef PG8_BAR
#undef PG8_SCHED
}
template <class Epi, class Sched, bool FP8 = false>
__device__ __forceinline__ void gemm_phase_gather(PG8_LAS unsigned char* lds, const Gemm g, const Sched& S, const Epi& E) {
    const int tid = threadIdx.x, wid = __builtin_amdgcn_readfirstlane(tid >> 6), lane = tid & 63, wr = wid >> 2, wc = wid & 3, fr = lane & 15, fq = lane >> 4;
    const int K = g.K, nt = K / BK;
    unsigned voffB[2]; int RA[2], CA[2];
#pragma unroll
    for (int i = 0; i < 2; ++i) { int R, C; stage_rc(tid * 16 + i * 8192, R, C); const int Rb = Epi::PERM ? ((R & ~31) + perm32(R & 31)) : R;
        RA[i] = R; CA[i] = C; voffB[i] = (unsigned)(Rb * g.ldb + C) * 2u; }
    const size_t kstep = (size_t)(BK * 2);
    const size_t hstepB = (size_t)HALF * g.ldb * 2, tstepB = 2 * hstepB;
    const unsigned ldsw = (unsigned)wid * 1024u;
    const int aoff = lds_byte(wr * 64 + fr, fq * 8), boff = lds_byte(wc * 32 + fr, fq * 8);
#define PG8_SA(b, h) (((b) * 2 + (h)) * HTB)
#define PG8_SB(b, h) ((4 + (b) * 2 + (h)) * HTB)
#define PG8_STAGE(bufoff, gbase, voff) do { _Pragma("unroll") for (int _i = 0; _i < 2; ++_i) \
        __builtin_amdgcn_global_load_lds((const unsigned*)((const char*)(gbase) + (voff)[_i]), (PG8_LAS unsigned*)(lds + (bufoff) + ldsw + _i * 8192), 16, 0, 0); } while (0)
#define PG8_LDA(dst, b, h) do { _Pragma("unroll") for (int m = 0; m < 4; ++m) { if constexpr (FP8) dst##8[m] = cat8(*(const PG8_LAS bf16x8*)(lds + PG8_SA(b, h) + aoff + m * 2048), *(const PG8_LAS bf16x8*)(lds + PG8_SA(b, h) + aoff + m * 2048 + 1024)); \
        else { _Pragma("unroll") for (int k = 0; k < 2; ++k) dst[m][k] = *(const PG8_LAS bf16x8*)(lds + PG8_SA(b, h) + aoff + m * 2048 + k * 1024); } } } while (0)
#define PG8_LDB(dst, b, h) do { _Pragma("unroll") for (int n = 0; n < 2; ++n) { if constexpr (FP8) dst##8[n] = cat8(*(const PG8_LAS bf16x8*)(lds + PG8_SB(b, h) + boff + n * 2048), *(const PG8_LAS bf16x8*)(lds + PG8_SB(b, h) + boff + n * 2048 + 1024)); \
        else { _Pragma("unroll") for (int k = 0; k < 2; ++k) dst[n][k] = *(const PG8_LAS bf16x8*)(lds + PG8_SB(b, h) + boff + n * 2048 + k * 1024); } } } while (0)
#define PG8_MMA(ai, bj, At, Bt) do { __builtin_amdgcn_s_setprio(1); _Pragma("unroll") for (int m = 0; m < 4; ++m) _Pragma("unroll") for (int n = 0; n < 2; ++n) { \
        if constexpr (FP8) asm volatile("v_mfma_scale_f32_16x16x128_f8f6f4 %0, %1, %2, %0, %3, %3 op_sel_hi:[0,0,0]" : "+v"(acc[ai][bj][m][n]) : "v"(Bt##8[n]), "v"(At##8[m]), "v"(fp8_unit_scale)); \
        else { _Pragma("unroll") for (int k = 0; k < 2; ++k) acc[ai][bj][m][n] = __builtin_amdgcn_mfma_f32_16x16x32_bf16(Bt[n][k], At[m][k], acc[ai][bj][m][n], 0, 0, 0); } } __builtin_amdgcn_s_setprio(0); } while (0)
#define PG8_WAIT_V(n) asm volatile("s_waitcnt vmcnt(" #n ")" ::: "memory")
#define PG8_WAIT_L(n) asm volatile("s_waitcnt lgkmcnt(" #n ")" ::: "memory")
#define PG8_BAR __builtin_amdgcn_s_barrier()
#define PG8_SCHED __builtin_amdgcn_sched_barrier(0)
#define PG8_ROWS(dst, ui_) do { _Pragma("unroll") for (int _h = 0; _h < 2; ++_h) _Pragma("unroll") for (int _i = 0; _i < 2; ++_i) \
        dst[_h][_i] = (unsigned)S.row_token((ui_), _h * HALF + RA[_i]) * (unsigned)(g.lda * 2) + (unsigned)(CA[_i] * 2); } while (0)
    Unit cur, nxt; int ui = 0;
    if (!S.next(0, cur)) return;
    f32x4 acc[2][2][4][2];
#pragma unroll
    for (int a = 0; a < 2; ++a)
#pragma unroll
        for (int b = 0; b < 2; ++b)
#pragma unroll
            for (int m = 0; m < 4; ++m)
#pragma unroll
                for (int n = 0; n < 2; ++n) acc[a][b][m][n] = (f32x4){0.f, 0.f, 0.f, 0.f};
    int fp8_unit_scale = 0x7F7F7F7F; asm volatile("" : "+v"(fp8_unit_scale));
    bf16x8 At[4][2], B0[2][2], B1[2][2];
    i32x8 At8[4], B08[2], B18[2];
    unsigned offC[2][2];
    PG8_ROWS(offC, 0);
    const char* gA = (const char*)g.A;
    const char* cB = (const char*)g.Bt + (size_t)cur.pn * tstepB;
    PG8_STAGE(PG8_SB(0, 0), cB, voffB); PG8_STAGE(PG8_SB(0, 1), cB + hstepB, voffB); PG8_STAGE(PG8_SA(0, 0), gA, offC[0]); PG8_STAGE(PG8_SA(0, 1), gA, offC[1]);
    if (wr == 1) PG8_BAR;
    PG8_WAIT_V(2); PG8_BAR;
    PG8_STAGE(PG8_SB(1, 0), cB + kstep, voffB); PG8_STAGE(PG8_SA(1, 0), gA + kstep, offC[0]); PG8_STAGE(PG8_SB(1, 1), cB + hstepB + kstep, voffB);
    PG8_WAIT_V(6); PG8_BAR;
    for (;;) {
        const bool has_next = S.next(ui + 1, nxt);
        const char* nB = has_next ? (const char*)g.Bt + (size_t)nxt.pn * tstepB : cB;
        for (int t = 0; t < nt; t += 2) {
            const bool last = (t == nt - 2);
            const char* a1 = gA + (size_t)(t + 1) * kstep;
            const char* a2 = last ? gA : gA + (size_t)(t + 2) * kstep; const char* b2 = last ? nB : cB + (size_t)(t + 2) * kstep;
            const char* a3 = a2 + kstep; const char* b3 = b2 + kstep;
            PG8_LDB(B0, 0, 0); PG8_LDB(B1, 0, 1); PG8_SCHED; PG8_LDA(At, 0, 0); PG8_STAGE(PG8_SA(1, 1), a1, offC[1]);
            if (last && has_next) { PG8_ROWS(offC, ui + 1); }
            PG8_WAIT_V(8); PG8_WAIT_L(0); PG8_BAR; PG8_MMA(0, 0, At, B0); PG8_MMA(0, 1, At, B1); PG8_BAR; PG8_SCHED;
            PG8_LDA(At, 0, 1); PG8_STAGE(PG8_SB(0, 0), b2, voffB); PG8_STAGE(PG8_SB(0, 1), b2 + hstepB, voffB); PG8_STAGE(PG8_SA(0, 0), a2, offC[0]);
            PG8_WAIT_V(8); PG8_WAIT_L(0); PG8_BAR; PG8_MMA(1, 0, At, B0); PG8_MMA(1, 1, At, B1); PG8_BAR; PG8_SCHED;
            PG8_LDB(B0, 1, 0); PG8_LDB(B1, 1, 1); PG8_SCHED; PG8_LDA(At, 1, 0); PG8_STAGE(PG8_SA(0, 1), a2, offC[1]);
            PG8_WAIT_V(8); PG8_WAIT_L(0); PG8_BAR; PG8_MMA(0, 0, At, B0); PG8_MMA(0, 1, At, B1); PG8_BAR; PG8_SCHED;
            PG8_LDA(At, 1, 1); PG8_STAGE(PG8_SB(1, 0), b3, voffB); PG8_STAGE(PG8_SB(1, 1), b3 + hstepB, voffB); PG8_STAGE(PG8_SA(1, 0), a3, offC[0]);
            PG8_WAIT_V(8); PG8_WAIT_L(0); PG8_BAR; PG8_MMA(1, 0, At, B0); PG8_MMA(1, 1, At, B1); PG8_BAR; PG8_SCHED;
        }
        if (wr == 0) PG8_BAR;
        if constexpr (FP8) asm volatile("s_nop 7\n\ts_nop 7" ::: "memory");
        E(acc, cur, wr, wc, fr, fq); S.done(cur);
        if (!has_next) break;
#pragma unroll
        for (int a = 0; a < 2; ++a)
#pragma unroll
            for (int b = 0; b < 2; ++b)
#pragma unroll
                for (int m = 0; m < 4; ++m)
#pragma unroll
                    for (int n = 0; n < 2; ++n) acc[a][b][m][n] = (f32x4){0.f, 0.f, 0.f, 0.f};
        cur = nxt; cB = nB; ++ui;
        if (wr == 1) PG8_BAR;
    }
    PG8_WAIT_V(0);
    PG8_BAR;
#undef PG8_ROWS
#undef PG8_SA
#undef PG8_SB
#undef PG8_STAGE
#undef PG8_LDA
#undef PG8_LDB
#undef PG8_MMA
#undef PG8_WAIT_V
#undef PG8_WAIT_L
#undef PG8_BAR
#undef PG8_SCHED
}
}

#ifndef MOE_UP_FP8
#define MOE_UP_FP8 1
#endif
#ifndef PROBE_NOATOM
#define PROBE_NOATOM 0
#endif
constexpr int T = 8192, D = 2048, NL = 2, BW = 512, ZC = 14336, INC = 14352;
constexpr int NE = 64, NEX = 65  , ED = 512;
constexpr int BRW = 4 * BW;
constexpr int HK = NEX * ED;
constexpr float ALPHA = 1.41421356237f;
constexpr float LN_EPS = 1e-5f;
constexpr float UPSC = MOE_UP_FP8 ? (1.f / 64.f) : 1.f;
constexpr int ZC_SBQ = 0, ZC_SBK = 512, ZC_SBV = 1024, ZC_GMU = 1536, ZC_GMV = 2048, ZC_GDN = 2560, ZC_GDNG = 4096,
              ZC_MLQ = 4608, ZC_MLK = 4864, ZC_MLV = 5120, ZC_MLO = 5632, ZC_GATE = 6144;

#define GAS __attribute__((address_space(1)))
#define LAS __attribute__((address_space(3)))
typedef unsigned short bf16;
typedef unsigned v4u __attribute__((ext_vector_type(4)));
typedef unsigned v2u __attribute__((ext_vector_type(2)));
typedef float v4f __attribute__((ext_vector_type(4)));
typedef float v2f __attribute__((ext_vector_type(2)));
#define LDS_WAIT() asm volatile("s_waitcnt lgkmcnt(0)" ::: "memory")
#define LDS_BAR() do { asm volatile("s_waitcnt lgkmcnt(0)" ::: "memory"); __builtin_amdgcn_s_barrier(); asm volatile("" ::: "memory"); } while (0)

constexpr size_t MiB = 1u << 20;
constexpr size_t WS_CTL = 0, CTL_ZERO_BYTES = 1 * MiB;
constexpr size_t WS_WIN = 2 * MiB, WS_WBR = 58 * MiB, WS_WOUT = 66 * MiB, WS_WUP = 74 * MiB, WS_WDN = 334 * MiB;
constexpr size_t WS_XB = 464 * MiB, WS_SMALL = 496 * MiB, WS_EG = 497 * MiB, WS_BETA = WS_EG + 256 * 1024, WS_COMB = 498 * MiB;
constexpr size_t WS_Z = 500 * MiB, WS_GQ = 724 * MiB, WS_GK = 740 * MiB, WS_GV = 756 * MiB, WS_GO = 772 * MiB, WS_HO = 788 * MiB;
constexpr size_t WS_BR = 804 * MiB, WS_MTMP = 836 * MiB, WS_MSUM = 900 * MiB, WS_Y = 932 * MiB, WS_X1 = 996 * MiB, WS_X1B = 1060 * MiB;
constexpr size_t WS_XCUR = 1092 * MiB, WS_HB = 1156 * MiB, WS_YEXP = 1236 * MiB, WS_LIST = 1524 * MiB, WS_WL = 1526 * MiB, WS_SLOT = 1528 * MiB, WS_MQ = 1530 * MiB, WS_MS = 1534 * MiB, WS_MK = 1538 * MiB, WS_MV = 1542 * MiB, WS_MFL = 1552 * MiB, WS_HDEN = WS_MFL + 65536, WS_VT = 1553 * MiB, WS_END = 1561 * MiB;
constexpr size_t WS_GU = WS_GQ, WS_GNW = WS_GK, WS_GQG = WS_GK + 8 * MiB, WS_GKT = WS_GV, WS_GAT = WS_GV + 8 * MiB, WS_GDL = WS_GV + 12 * MiB;
constexpr int HROWS = 73728;
static_assert(WS_HB + (size_t)HROWS * ED * 2 <= WS_YEXP && WS_YEXP + (size_t)HROWS * D * 2 <= WS_LIST, "ws map (moe)");
static_assert(WS_WIN + (size_t)ZC * D * 2 <= WS_WBR && WS_WUP + (size_t)NEX * 1024 * D * 2 <= WS_WDN && WS_WDN + (size_t)D * HK * 2 <= WS_XB, "ws map (weights)");
static_assert(WS_Z + (size_t)T * ZC * 2 <= WS_GQ, "ws map (acts)");
constexpr int CW_BAR = 4096, CW_CNT = 16384;
constexpr int TAB_OFF = 131072 + 1024;
constexpr int LDS_BYTES = 163840, MISC_OFF = 131072 + 320;

__device__ __forceinline__ float bflo(unsigned w) { return __uint_as_float(w << 16); }
__device__ __forceinline__ float bfhi(unsigned w) { return __uint_as_float(w & 0xffff0000u); }
__device__ __forceinline__ unsigned f2bf(float f) { unsigned u = __float_as_uint(f); return (u + 0x7fffu + ((u >> 16) & 1u)) >> 16; }
__device__ __forceinline__ unsigned pk2(float lo, float hi) { return f2bf(lo) | (f2bf(hi) << 16); }
template <int CTRL> __device__ __forceinline__ float dpp(float x) { return __builtin_bit_cast(float, __builtin_amdgcn_mov_dpp(__builtin_bit_cast(int, x), CTRL, 0xf, 0xf, true)); }
__device__ __forceinline__ float sum4(float x) { x += dpp<0xB1>(x); x += dpp<0x4E>(x); return x; }
__device__ __forceinline__ float sum8(float x) { x = sum4(x); x += dpp<0x141>(x); return x; }
__device__ __forceinline__ float sum16(float x) { x = sum8(x); x += dpp<0x140>(x); return x; }
__device__ __forceinline__ float wave_sum(float x) { x = sum16(x); x += __shfl_xor(x, 16); x += __shfl_xor(x, 32); return x; }
__device__ __forceinline__ float max8(float x) { x = fmaxf(x, dpp<0xB1>(x)); x = fmaxf(x, dpp<0x4E>(x)); x = fmaxf(x, dpp<0x141>(x)); return x; }
__device__ __forceinline__ float min8(float x) { x = fminf(x, dpp<0xB1>(x)); x = fminf(x, dpp<0x4E>(x)); x = fminf(x, dpp<0x141>(x)); return x; }
__device__ __forceinline__ float wave_scan_incl(float v) {
    v += __builtin_bit_cast(float, __builtin_amdgcn_update_dpp(0, __builtin_bit_cast(int, v), 0x111, 0xf, 0xf, true));
    v += __builtin_bit_cast(float, __builtin_amdgcn_update_dpp(0, __builtin_bit_cast(int, v), 0x112, 0xf, 0xf, true));
    v += __builtin_bit_cast(float, __builtin_amdgcn_update_dpp(0, __builtin_bit_cast(int, v), 0x114, 0xf, 0xf, true));
    v += __builtin_bit_cast(float, __builtin_amdgcn_update_dpp(0, __builtin_bit_cast(int, v), 0x118, 0xf, 0xf, true));
    v += __builtin_bit_cast(float, __builtin_amdgcn_update_dpp(0, __builtin_bit_cast(int, v), 0x142, 0xa, 0xf, false));
    v += __builtin_bit_cast(float, __builtin_amdgcn_update_dpp(0, __builtin_bit_cast(int, v), 0x143, 0xc, 0xf, false));
    return v;
}
__device__ __forceinline__ float sigmoidf_(float x) { return 1.f / (1.f + __expf(-x)); }
__device__ __forceinline__ float siluf_(float x) { return x / (1.f + __expf(-x)); }
__device__ __forceinline__ float softplusf_(float x) { return fmaxf(x, 0.f) + __logf(1.f + __expf(-fabsf(x))); }
__device__ __forceinline__ float gelu_tanh(float x) { const float y = 0.7978845608f * (x + 0.044715f * x * x * x); const float t = 1.f - 2.f / (__expf(2.f * y) + 1.f); return 0.5f * x * (1.f + t); }
__device__ __forceinline__ void unpack8(const v4u r, float (&f)[8]) { f[0] = bflo(r.x); f[1] = bfhi(r.x); f[2] = bflo(r.y); f[3] = bfhi(r.y); f[4] = bflo(r.z); f[5] = bfhi(r.z); f[6] = bflo(r.w); f[7] = bfhi(r.w); }
#define XB_TMO      128
#define XB_XCNT(j)  (256  + 64 * (j))
#define XB_XSUB(j)  (1280 + 64 * (j))
#define XB_XGEN(j)  (2304 + 64 * (j))
#define XB_TOP      3328
#define XB_TOPGEN   3392
#define XCD_BAR_WORDS 3456
#define XB_SPIN_CAP (1u << 18)

__device__ __forceinline__ unsigned xb_ld(unsigned* p)              { return __hip_atomic_load(p, __ATOMIC_RELAXED, __HIP_MEMORY_SCOPE_AGENT); }
__device__ __forceinline__ unsigned xb_add(unsigned* p, unsigned v) { return __hip_atomic_fetch_add(p, v, __ATOMIC_RELAXED, __HIP_MEMORY_SCOPE_AGENT); }
__device__ __forceinline__ unsigned xb_xcc_id() { return (unsigned)__builtin_amdgcn_s_getreg((3 << 11) | 20) & 0xFu; }
#define XB_SPIN(cond, bar) do { unsigned _sp = 0; while (cond) { __builtin_amdgcn_s_sleep(1); \
    if ((++_sp & 255u) == 0u) { if (xb_ld(&(bar)[XB_TMO])) break; if (_sp > XB_SPIN_CAP) { atomicAdd(&(bar)[XB_TMO], 1u); break; } } } } while (0)

struct XcdBarrier {
    unsigned* bar; unsigned x;
    volatile LAS unsigned* st;
};

__device__ __forceinline__ XcdBarrier xcd_barrier_post(unsigned* bar, volatile LAS unsigned* st) {
    XcdBarrier b; b.bar = bar; b.x = xb_xcc_id(); b.st = st;
    if (threadIdx.x == 0) (void)xb_add(&bar[XB_XCNT(b.x)], 1u);
    return b;
}
__device__ __forceinline__ void xcd_barrier_complete(unsigned* bar, unsigned x, unsigned& nloc, unsigned& nx) {
    const unsigned G = gridDim.x * gridDim.y * gridDim.z;
    unsigned sum, cnt, mine, sp = 0u;
    for (;;) {
        sum = 0u; cnt = 0u; mine = 0u;
#pragma unroll
        for (unsigned j = 0; j < 16; ++j) { const unsigned c = xb_ld(&bar[XB_XCNT(j)]); sum += c; cnt += (c > 0u) ? 1u : 0u; mine = (j == x) ? c : mine; }
        if (sum == G) break;
        __builtin_amdgcn_s_sleep(1);
        if ((++sp & 255u) == 0u) { if (xb_ld(&bar[XB_TMO])) break; if (sp > XB_SPIN_CAP) { atomicAdd(&bar[XB_TMO], 1u); break; } }
    }
    nloc = mine > 0u ? mine : 1u; nx = cnt > 0u ? cnt : 1u;
}

__device__ __forceinline__ void xcd_barrier(const XcdBarrier& b) {
    asm volatile("s_waitcnt vmcnt(0)" ::: "memory");
    __syncthreads();
    if (threadIdx.x == 0) {
        unsigned* bar = b.bar;
        __builtin_amdgcn_s_waitcnt(0);
        unsigned nloc = b.st[0], nx = b.st[1];
        if (nloc == 0u) { xcd_barrier_complete(bar, b.x, nloc, nx); b.st[0] = nloc; b.st[1] = nx; }
        const unsigned old = xb_add(&bar[XB_XSUB(b.x)], 1u);
        const unsigned gen = old / nloc;
        if (old + 1u == (gen + 1u) * nloc) {
            __builtin_amdgcn_fence(__ATOMIC_RELEASE, "agent");
            asm volatile("s_waitcnt vmcnt(0)" ::: "memory");
            const unsigned og = xb_add(&bar[XB_TOP], 1u);
            const unsigned tg = og / nx;
            if (og + 1u == (tg + 1u) * nx) xb_add(&bar[XB_TOPGEN], 1u);
            else XB_SPIN(xb_ld(&bar[XB_TOPGEN]) == tg, bar);
            __builtin_amdgcn_fence(__ATOMIC_ACQUIRE, "agent");
            xb_add(&bar[XB_XGEN(b.x)], 1u);
            asm volatile("s_waitcnt vmcnt(0)" ::: "memory");
        } else {
            XB_SPIN(xb_ld(&bar[XB_XGEN(b.x)]) == gen, bar);
            __builtin_amdgcn_fence(__ATOMIC_ACQUIRE, "agent");
            asm volatile("s_waitcnt vmcnt(0)" ::: "memory");
        }
    }
    __syncthreads();
}

struct Params { const float* in[27]; float* out; unsigned char* ws; int ph_lo, ph_hi; };
enum { I_X = 0, I_WIN, I_GMNG, I_GMNB, I_GMWS, I_GMBS, I_CONVW, I_ALOG, I_DTB, I_GDNNG, I_MLIB, I_MLFB, I_MLNG, I_WBR, I_WOUT, I_LN1G, I_LN1B,
       I_WR, I_RB, I_WG, I_WU, I_WD, I_SG, I_SU, I_SD, I_LN2G, I_LN2B };

using pg8::f32x4; using pg8::u32x4; using pg8::Unit; using pg8::HALF; using pg8::BM;

struct EpiMergeH {
    static constexpr bool PERM = true, AFTER_DRAIN = false; static constexpr int MID = BW / pg8::BK;
    const bf16* Z; bf16* msum;
    __device__ __forceinline__ void mid(f32x4 (&acc)[2][2][4][2], const Unit& u, int j, int wr, int wc, int fr, int fq) const {
        int row0 = u.pm * BM + wr * 64 + fr; const int col0 = u.pn * BM + wc * 32 + 8 * fq; asm volatile("" : "+v"(row0));
        const bf16* zp = Z + ZC_GATE + (size_t)(j - 1) * D + col0;
#pragma unroll
        for (int am = 0; am < 4; ++am) { const int ai = am >> 1, m0 = (am & 1) * 2; v4u ga[2][2], gb[2][2];
#pragma unroll
            for (int m = 0; m < 2; ++m)
#pragma unroll
                for (int bj = 0; bj < 2; ++bj) { const bf16* q = zp + (size_t)(row0 + ai * HALF + (m0 + m) * 16) * ZC + bj * HALF; ga[m][bj] = *(const v4u*)q; gb[m][bj] = *(const v4u*)(q + D); }
#pragma unroll
            for (int m = 0; m < 2; ++m)
#pragma unroll
                for (int bj = 0; bj < 2; ++bj) { float a[8], b[8]; unpack8(ga[m][bj], a); unpack8(gb[m][bj], b);
#pragma unroll
                    for (int i = 0; i < 8; ++i) { const float ea = __builtin_amdgcn_exp2f(fmaxf(a[i], -60.f) * -1.44269504f), eb = __builtin_amdgcn_exp2f(fmaxf(b[i], -60.f) * -1.44269504f);
                        acc[ai][bj][m0 + m][i >> 2][i & 3] *= (1.f + eb) * __builtin_amdgcn_rcpf(1.f + ea); } }
            asm volatile("" ::: "memory"); }
    }
    __device__ __forceinline__ void operator()(const f32x4 (&acc)[2][2][4][2], const Unit& u, int wr, int wc, int fr, int fq) const {
        const int row0 = u.pm * BM + wr * 64 + fr, col0 = u.pn * BM + wc * 32 + 8 * fq;
#pragma unroll
        for (int ai = 0; ai < 2; ++ai) { v4u gg[4][2];
#pragma unroll
            for (int m = 0; m < 4; ++m)
#pragma unroll
                for (int bj = 0; bj < 2; ++bj) gg[m][bj] = *(const v4u*)(Z + (size_t)(row0 + ai * HALF + m * 16) * ZC + ZC_GATE + 3 * D + col0 + bj * HALF);
#pragma unroll
            for (int m = 0; m < 4; ++m)
#pragma unroll
                for (int bj = 0; bj < 2; ++bj) { const size_t row = (size_t)(row0 + ai * HALF + m * 16); const int col = col0 + bj * HALF; float gl[8]; unpack8(gg[m][bj], gl);
                    f32x4 v0 = acc[ai][bj][m][0], v1 = acc[ai][bj][m][1];
#pragma unroll
                    for (int j = 0; j < 4; ++j) { v0[j] *= sigmoidf_(gl[j]); v1[j] *= sigmoidf_(gl[4 + j]); }
                    unsigned w0 = 0, w1 = 0; w0 = __builtin_amdgcn_cvt_pk_fp8_f32(v0[0], v0[1], w0, false); w0 = __builtin_amdgcn_cvt_pk_fp8_f32(v0[2], v0[3], w0, true); w1 = __builtin_amdgcn_cvt_pk_fp8_f32(v1[0], v1[1], w1, false); w1 = __builtin_amdgcn_cvt_pk_fp8_f32(v1[2], v1[3], w1, true);
                    *(v2u*)((unsigned char*)msum + row * D + col) = (v2u){w0, w1}; }
            asm volatile("" ::: "memory"); }
    }
};
struct EpiResid {
    static constexpr bool PERM = false, AFTER_DRAIN = false; static constexpr int MID = 0;
    const float* X; float* Y; float sc;
    __device__ __forceinline__ void operator()(const f32x4 (&acc)[2][2][4][2], const Unit& u, int wr, int wc, int fr, int fq) const {
        const int row0 = u.pm * BM + wr * 64 + fr, col0 = u.pn * BM + wc * 32 + 4 * fq;
#pragma unroll
        for (int ai = 0; ai < 2; ++ai)
#pragma unroll
            for (int m = 0; m < 4; ++m) { const size_t off = (size_t)(row0 + ai * HALF + m * 16) * D + col0;
#pragma unroll
                for (int bj = 0; bj < 2; ++bj)
#pragma unroll
                    for (int n = 0; n < 2; ++n) { const f32x4 xv = *(const f32x4*)(X + off + bj * HALF + n * 16); *(f32x4*)(Y + off + bj * HALF + n * 16) = xv * ALPHA + acc[ai][bj][m][n] * sc; } }
    }
};
struct MoeTab {
    LAS int* t; LAS unsigned short* tok; LAS float* wt; LAS unsigned char* mte;
    __device__ __forceinline__ MoeTab(LAS unsigned char* lds) : t((LAS int*)(lds + TAB_OFF)), tok((LAS unsigned short*)(lds + TAB_OFF + 1024)), wt((LAS float*)(lds + TAB_OFF + 5120)), mte((LAS unsigned char*)(lds + TAB_OFF + 13312)) {}
};
__device__ __forceinline__ void moe_tables(const MoeTab& M, const unsigned* cnt  , int tid, int lane, int wave) {
    __syncthreads();
    if (wave == 0) { const int c = (int)cnt[64 * lane]; const int tiles = (c + 255) >> 8; const float incl = wave_scan_incl((float)tiles);
        M.t[80 + lane] = c; M.t[lane] = (int)incl - tiles; if (lane == 63) { M.t[64] = (int)incl; M.t[65] = (int)incl + T / 256; M.t[80 + 64] = T; } }
    __syncthreads();
    const int Mt = M.t[65];
    for (int mt = tid; mt < Mt; mt += 512) { int e = 0;
        for (int k = 1; k <= 64; ++k) e = (M.t[k] <= mt) ? k : e;
        M.mte[mt] = (unsigned char)e; }
    __syncthreads();
}
struct UpOrder {
    MoeTab M; int n;
    __device__ __forceinline__ bool next(int i, Unit& u) const { if (i >= n) return false; u.pm = M.t[168 + i]; u.pn = M.t[176 + i]; u.aux = i; return true; }
    __device__ __forceinline__ int row_token(int i, int r) const { return (int)M.tok[i * 256 + r]; }
    __device__ __forceinline__ void a_ready(const Unit&) const {}
    __device__ __forceinline__ void done(const Unit&) const {}
};
__device__ __forceinline__ int up_order_build(const MoeTab& M, const int* LIST, const float* WL, int wg, int G, int tid) {
    const int U = 4 * M.t[65];
    if (tid < 8) { const int L = tid * G + wg; if (L < U) { const int mt = L >> 2, q = L & 3, e = M.mte[mt]; M.t[168 + tid] = mt; M.t[176 + tid] = e * 4 + q; M.t[184 + tid] = e; M.t[192 + tid] = mt - M.t[e]; } }
    int n = 0;
#pragma unroll
    for (int i = 0; i < 8; ++i) n += (i * G + wg < U) ? 1 : 0;
    __syncthreads();
    for (int idx = tid; idx < n * 256; idx += 512) { const int i = idx >> 8, r = idx & 255, e = M.t[184 + i], li = M.t[192 + i] * 256 + r;
        int tk = 0; float w = 0.f;
        if (e < NE) { if (li < M.t[80 + e]) { tk = LIST[e * T + li]; w = WL[e * T + li]; } } else { tk = li; w = 1.f; }
        M.tok[idx] = (unsigned short)tk; M.wt[idx] = w; }
    __syncthreads();
    return n;
}
struct EpiGluSparse {
    static constexpr bool PERM = true, AFTER_DRAIN = false; static constexpr int MID = 0;
    LAS const float* wt; bf16* H;
    __device__ __forceinline__ void operator()(const f32x4 (&acc)[2][2][4][2], const Unit& u, int wr, int wc, int fr, int fq) const {
        const int q = u.pn & 3; const int rl0 = wr * 64 + fr, col0 = q * 128 + wc * 32 + 8 * fq;
#pragma unroll
        for (int ai = 0; ai < 2; ++ai)
#pragma unroll
            for (int m = 0; m < 4; ++m) { const int rl = rl0 + ai * HALF + m * 16; const float c = wt[u.aux * 256 + rl]; float h[8];
#pragma unroll
                for (int n = 0; n < 2; ++n)
#pragma unroll
                    for (int j = 0; j < 4; ++j) h[4 * n + j] = siluf_(acc[ai][0][m][n][j] * UPSC) * (acc[ai][1][m][n][j] * UPSC) * c;
                u32x4 w; w.x = pk2(h[0], h[1]); w.y = pk2(h[2], h[3]); w.z = pk2(h[4], h[5]); w.w = pk2(h[6], h[7]);
                *(u32x4*)(H + ((size_t)u.pm * 256 + rl) * ED + col0) = w; }
    }
};
struct DownOrder {
    MoeTab M; int G, c, U;
    __device__ __forceinline__ bool next(int i, Unit& u) const { const int L = i * G + c; if (L >= U) return false; const int mt = L >> 3; u.pm = mt; u.pn = (int)M.mte[mt] * 8 + (L & 7); u.aux = 0; return true; }
    __device__ __forceinline__ void a_ready(const Unit&) const {}
    __device__ __forceinline__ void done(const Unit&) const {}
};
struct EpiYexp {
    static constexpr bool PERM = true, AFTER_DRAIN = false; static constexpr int MID = 0;
    bf16* Y;
    __device__ __forceinline__ void operator()(const f32x4 (&acc)[2][2][4][2], const Unit& u, int wr, int wc, int fr, int fq) const {
        const int row0 = u.pm * BM + wr * 64 + fr, col0 = (u.pn & 7) * BM + wc * 32 + 8 * fq;
#pragma unroll
        for (int ai = 0; ai < 2; ++ai)
#pragma unroll
            for (int m = 0; m < 4; ++m) { bf16* rowp = Y + (size_t)(row0 + ai * HALF + m * 16) * D + col0;
#pragma unroll
                for (int bj = 0; bj < 2; ++bj) { const f32x4 v0 = acc[ai][bj][m][0], v1 = acc[ai][bj][m][1];
                    u32x4 w; w.x = pk2(v0[0], v0[1]); w.y = pk2(v0[2], v0[3]); w.z = pk2(v1[0], v1[1]); w.w = pk2(v1[2], v1[3]); *(u32x4*)(rowp + bj * HALF) = w; } }
    }
};

struct TrItem { const float* src; bf16* dst; unsigned sld, dld; int f8; };
__device__ __forceinline__ void tr_load(const TrItem& t, int lane, v4f (&v)[8]) { const int r8 = lane >> 3, c4 = lane & 7;
#pragma unroll
    for (int i = 0; i < 8; ++i) v[i] = *(const v4f*)(t.src + (size_t)(8 * i + r8) * t.sld + 4 * c4); }
__device__ __forceinline__ void tr_store(const TrItem& t, const v4f (&v)[8], LAS float* scr, int lane) {
    { const int r8 = lane >> 3, c4 = lane & 7;
#pragma unroll
      for (int i = 0; i < 8; ++i) { LAS float* d = scr + (8 * i + r8) * 33 + 4 * c4; d[0] = v[i].x; d[1] = v[i].y; d[2] = v[i].z; d[3] = v[i].w; } }
    LDS_WAIT(); asm volatile("" ::: "memory");
    if (t.f8) {
        const int c = lane & 3;
#pragma unroll
        for (int j = 0; j < 2; ++j) { const int n = (lane >> 2) + 16 * j; const LAS float* s = scr + (16 * c) * 33 + n; unsigned w[4];
#pragma unroll
            for (int q = 0; q < 4; ++q) { unsigned x = 0; x = __builtin_amdgcn_cvt_pk_fp8_f32(s[(4 * q) * 33] * 64.f, s[(4 * q + 1) * 33] * 64.f, x, false); x = __builtin_amdgcn_cvt_pk_fp8_f32(s[(4 * q + 2) * 33] * 64.f, s[(4 * q + 3) * 33] * 64.f, x, true); w[q] = x; }
            *(v4u*)((unsigned char*)t.dst + (size_t)n * t.dld + 16 * c) = (v4u){w[0], w[1], w[2], w[3]}; }
    } else {
        const int c = lane & 7;
#pragma unroll
        for (int j = 0; j < 4; ++j) { const int n = (lane >> 3) + 8 * j; const LAS float* s = scr + (8 * c) * 33 + n;
            v4u o; o.x = pk2(s[0 * 33], s[1 * 33]); o.y = pk2(s[2 * 33], s[3 * 33]); o.z = pk2(s[4 * 33], s[5 * 33]); o.w = pk2(s[6 * 33], s[7 * 33]);
            *(v4u*)(t.dst + (size_t)n * t.dld + 8 * c) = o; }
    }
    LDS_WAIT(); asm volatile("" ::: "memory");
}
template <int PART> __device__ __forceinline__ TrItem tr_decode(const Params& p, int l, int it) {
    unsigned char* ws = p.ws;
    constexpr int N_IN = (ZC / 32) * (D / 64), N_BR = 4 * (BW / 64) * (D / 32), N_OUT = (D / 64) * (D / 32), N_UP = NEX * 2 * (D / 64) * (ED / 32);
    int r = it; TrItem t; t.f8 = 0;
    if (PART == 0) {
        const float* w_in = p.in[I_WIN] + (size_t)l * D * INC; const float* w_br = p.in[I_WBR] + (size_t)l * 4 * BW * D; const float* w_out = p.in[I_WOUT] + (size_t)l * D * D;
        bf16* WIN = (bf16*)(ws + WS_WIN); bf16* WBR = (bf16*)(ws + WS_WBR); bf16* WOUT = (bf16*)(ws + WS_WOUT);
        if (r < N_IN) { const int kb = r / (ZC / 32), n0 = (r % (ZC / 32)) * 32, k0 = kb * 64; const int sc = n0 + (n0 >= ZC_GATE ? 16 : (n0 >= ZC_MLQ ? 8 : 0));
            t.src = w_in + (size_t)k0 * INC + sc; t.sld = INC; t.dst = (bf16*)((unsigned char*)WIN + (size_t)n0 * D + k0); t.dld = D; t.f8 = 1; return t; } r -= N_IN;
        if (r < N_BR) { const int g = r / 512, rr = r % 512, k0 = (rr / 64) * 64, n0 = (rr % 64) * 32;
            t.src = w_br + ((size_t)g * BW + k0) * D + n0; t.sld = D; t.dst = WBR + (size_t)n0 * BRW + g * BW + k0; t.dld = BRW; return t; } r -= N_BR;
        { const int k0 = (r / 64) * 64, n0 = (r % 64) * 32; t.src = w_out + (size_t)k0 * D + n0; t.sld = D; t.dst = (bf16*)((unsigned char*)WOUT + (size_t)n0 * D + k0); t.dld = D; t.f8 = 1; return t; }
    } else {
        const float* w_g = p.in[I_WG] + (size_t)l * NE * D * ED; const float* w_u = p.in[I_WU] + (size_t)l * NE * D * ED; const float* w_d = p.in[I_WD] + (size_t)l * NE * ED * D;
        const float* s_g = p.in[I_SG] + (size_t)l * D * ED; const float* s_u = p.in[I_SU] + (size_t)l * D * ED; const float* s_d = p.in[I_SD] + (size_t)l * ED * D;
        bf16* WUP = (bf16*)(ws + WS_WUP); bf16* WDN = (bf16*)(ws + WS_WDN);
        if (r < N_UP) { const int e = r / 1024, rr = r % 1024, mat = rr / 512, r2 = rr % 512, k0 = (r2 / 16) * 64, n0 = (r2 % 16) * 32;
            const float* sb = (e < NE) ? ((mat ? w_u : w_g) + (size_t)e * D * ED) : (mat ? s_u : s_g);
            const int drow = e * 1024 + (n0 / 128) * 256 + mat * 128 + (n0 % 128);
            t.src = sb + (size_t)k0 * ED + n0; t.sld = ED;
#if MOE_UP_FP8
            t.dst = (bf16*)((unsigned char*)WUP + (size_t)drow * D + k0); t.dld = D; t.f8 = 1; return t; }
#else
            t.dst = WUP + (size_t)drow * D + k0; t.dld = D; return t; }
#endif
        r -= N_UP;
        { const int e = r / 512, rr = r % 512, k0 = (rr / 64) * 64, n0 = (rr % 64) * 32;
            const float* sb = (e < NE) ? (w_d + (size_t)e * ED * D) : s_d;
            t.src = sb + (size_t)k0 * D + n0; t.sld = D; t.dst = WDN + ((size_t)e * D + n0) * ED + k0; t.dld = ED; return t; }
    }
}
template <int PART> __device__ __forceinline__ void phase_convert(const Params& p, int l, LAS unsigned char* lds, int gw, int NGW, int wave, int lane) {
    constexpr int N_IN = (ZC / 32) * (D / 64), N_BR = 4 * (BW / 64) * (D / 32), N_OUT = (D / 64) * (D / 32), N_UP = NEX * 2 * (D / 64) * (ED / 32), N_DN = NEX * (ED / 64) * (D / 32);
    constexpr int NITEMS = (PART == 0) ? (N_IN + N_BR + N_OUT) : (N_UP + N_DN);
    LAS float* scr = (LAS float*)(lds + wave * 16384);
    if (gw >= NITEMS) return;
    TrItem cur = tr_decode<PART>(p, l, gw); v4f va[8], vb[8];
    tr_load(cur, lane, va);
    for (int it = gw; it < NITEMS; it += 2 * NGW) {
        const int i1 = it + NGW, i2 = it + 2 * NGW; TrItem nx = cur;
        if (i1 < NITEMS) { nx = tr_decode<PART>(p, l, i1); } tr_load(nx, lane, vb);
        tr_store(cur, va, scr, lane);
        if (i1 >= NITEMS) break;
        cur = nx; if (i2 < NITEMS) { cur = tr_decode<PART>(p, l, i2); } tr_load(cur, lane, va);
        tr_store(nx, vb, scr, lane);
        if (i2 >= NITEMS) break;
    }
}
__device__ __forceinline__ void phase_xprep(const Params& p, int l, const float* xin, LAS unsigned char* lds, int gw, int NGW, int tid, int lane) {
    const float* w_in = p.in[I_WIN] + (size_t)l * D * INC; LAS float* wsm = (LAS float*)lds;
    __syncthreads();
    for (int idx = tid; idx < D * 16; idx += 512) { const int d = idx >> 4, c = idx & 15; wsm[c * D + d] = w_in[(size_t)d * INC + (c < 8 ? 4608 + c : 6152 + (c - 8))]; }
    __syncthreads();
    bf16* XB = (bf16*)(p.ws + WS_XB); float* SMALL = (float*)(p.ws + WS_SMALL);
    for (int m = gw; m < T; m += NGW) {
        const v4f* xr = (const v4f*)(xin + (size_t)m * D) + lane; v4f v[8];
#pragma unroll
        for (int j = 0; j < 8; ++j) v[j] = xr[64 * j];
        unsigned* xo = (unsigned*)((unsigned char*)XB + (size_t)m * D) + lane;
#pragma unroll
        for (int j = 0; j < 8; ++j) { unsigned w = 0; w = __builtin_amdgcn_cvt_pk_fp8_f32(v[j].x, v[j].y, w, false); w = __builtin_amdgcn_cvt_pk_fp8_f32(v[j].z, v[j].w, w, true); xo[64 * j] = w; }
        float res = 0.f;
#pragma unroll 1
        for (int c = 0; c < 16; ++c) { float a = 0.f;
#pragma unroll
            for (int j = 0; j < 8; ++j) { const v4f w = *(const LAS v4f*)(wsm + c * D + 4 * lane + 256 * j); a += v[j].x * w.x + v[j].y * w.y + v[j].z * w.z + v[j].w * w.w; }
            a = wave_sum(a); if (lane == c) res = a; }
        if (lane < 16) SMALL[(size_t)m * 16 + lane] = res;
    }
    __syncthreads();
}


typedef short bf16x8_t __attribute__((ext_vector_type(8)));
__device__ __forceinline__ void ml_pre_item(const Params& p, int l, LAS unsigned char* lds, int item, int tid, int wave, int lane) {
    const int h = item & 3, n = item >> 2; const size_t t0 = (size_t)n * 64;
    const bf16* Z = (const bf16*)(p.ws + WS_Z); const float* SMALL = (const float*)(p.ws + WS_SMALL);
    bf16* MQ = (bf16*)(p.ws + WS_MQ) + (size_t)item * 4096; bf16* MS = (bf16*)(p.ws + WS_MS) + (size_t)item * 4096; bf16* MK = (bf16*)(p.ws + WS_MK) + (size_t)item * 4096;
    bf16* MV = (bf16*)(p.ws + WS_MV) + (size_t)item * 9216; float* MFL = (float*)(p.ws + WS_MFL);
    LAS float* qs = (LAS float*)lds;
    LAS float* ks = qs + 64 * 65;
    LAS float* bs = ks + 64 * 65;
    LAS unsigned short* vs = (LAS unsigned short*)(bs + 128);
    { const int tk = tid >> 3, c8 = tid & 7; float f[8];
      unpack8(*(const v4u*)(Z + (t0 + tk) * ZC + ZC_MLQ + h * 64 + 8 * c8), f);
#pragma unroll
      for (int i = 0; i < 8; ++i) qs[tk * 65 + 8 * c8 + i] = f[i];
      unpack8(*(const v4u*)(Z + (t0 + tk) * ZC + ZC_MLK + h * 64 + 8 * c8), f);
#pragma unroll
      for (int i = 0; i < 8; ++i) ks[tk * 65 + 8 * c8 + i] = f[i]; }
#pragma unroll
    for (int r = 0; r < 2; ++r) { const int idx = tid + 512 * r, tk = idx >> 4, c8 = idx & 15;
        *(LAS v4u*)(vs + tk * 136 + 8 * c8) = *(const v4u*)(Z + (t0 + tk) * ZC + ZC_MLV + h * 128 + 8 * c8); }
    if (wave == 0) { const float fp = SMALL[(t0 + lane) * 16 + 12 + h] + p.in[I_MLFB][l * 4 + h]; const float lf = -softplusf_(-fp);
        bs[lane] = wave_scan_incl(lf); bs[64 + lane] = SMALL[(t0 + lane) * 16 + 8 + h] + p.in[I_MLIB][l * 4 + h]; }
    __syncthreads();
    const float blast = bs[63];
    { const int i = tid >> 3, jb = tid & 7; const float bi = bs[i];
      { const float e = __expf(bi) * 0.125f; float o[8];
#pragma unroll
        for (int x = 0; x < 8; ++x) o[x] = qs[i * 65 + 8 * jb + x] * e;
        v4u w; w.x = pk2(o[0], o[1]); w.y = pk2(o[2], o[3]); w.z = pk2(o[4], o[5]); w.w = pk2(o[6], o[7]); *(v4u*)(MQ + i * 64 + 8 * jb) = w; }
      { float d[8];
#pragma unroll
        for (int x = 0; x < 8; ++x) d[x] = 0.f;
        if (8 * jb <= i) {
            for (int dd = 0; dd < 64; ++dd) { const float qv = qs[i * 65 + dd];
#pragma unroll
                for (int x = 0; x < 8; ++x) d[x] += qv * ks[(8 * jb + x) * 65 + dd]; }
#pragma unroll
            for (int x = 0; x < 8; ++x) { const int j = 8 * jb + x; d[x] = (j <= i) ? __expf(bi - bs[j] + bs[64 + j]) * d[x] * 0.125f : 0.f; } }
        v4u w; w.x = pk2(d[0], d[1]); w.y = pk2(d[2], d[3]); w.z = pk2(d[4], d[5]); w.w = pk2(d[6], d[7]); *(v4u*)(MS + i * 64 + 8 * jb) = w; }
      { float o[8];
#pragma unroll
        for (int x = 0; x < 8; ++x) { const int j = 8 * jb + x; o[x] = ks[j * 65 + i] * __expf(blast - bs[j] + bs[64 + j]); }
        v4u w; w.x = pk2(o[0], o[1]); w.y = pk2(o[2], o[3]); w.z = pk2(o[4], o[5]); w.w = pk2(o[6], o[7]); *(v4u*)(MK + i * 64 + 8 * jb) = w; }
    }
    { const int c = tid >> 2, jq = tid & 3; unsigned w[8];
#pragma unroll
      for (int x = 0; x < 8; ++x) w[x] = (unsigned)vs[(16 * jq + 2 * x) * 136 + c] | ((unsigned)vs[(16 * jq + 2 * x + 1) * 136 + c] << 16);
      *(v4u*)(MV + c * 64 + 16 * jq) = (v4u){w[0], w[1], w[2], w[3]}; *(v4u*)(MV + c * 64 + 16 * jq + 8) = (v4u){w[4], w[5], w[6], w[7]};
      if (tid < 64) { const int c2 = 128 + (tid >> 2); const unsigned one = (c2 == 128) ? 0x3F803F80u : 0u;
          *(v4u*)(MV + c2 * 64 + 16 * jq) = (v4u){one, one, one, one}; *(v4u*)(MV + c2 * 64 + 16 * jq + 8) = (v4u){one, one, one, one}; } }
    if (tid == 0) MFL[item] = __expf(blast);
    __syncthreads();
}
struct MlFrags { bf16x8_t q[2], s[2], kt[2], vt[2]; float fl; };
__device__ __forceinline__ void ml_load(MlFrags& F, const Params& p, int item, int offA, int offV) {
    const bf16* MQ = (const bf16*)(p.ws + WS_MQ) + (size_t)item * 4096; const bf16* MS = (const bf16*)(p.ws + WS_MS) + (size_t)item * 4096; const bf16* MK = (const bf16*)(p.ws + WS_MK) + (size_t)item * 4096;
    const bf16* MV = (const bf16*)(p.ws + WS_MV) + (size_t)item * 9216;
#pragma unroll
    for (int ks = 0; ks < 2; ++ks) { F.q[ks] = *(const bf16x8_t*)(MQ + offA + 32 * ks); F.s[ks] = *(const bf16x8_t*)(MS + offA + 32 * ks); F.kt[ks] = *(const bf16x8_t*)(MK + offA + 32 * ks); F.vt[ks] = *(const bf16x8_t*)(MV + offV + 32 * ks); }
    F.fl = ((const float*)(p.ws + WS_MFL))[item];
}
__device__ __forceinline__ void ml_seq(const Params& p, LAS unsigned char* lds, int wgi, int wave, int lane) {
    const int u = wgi * 2 + (wave >> 2), wi = wave & 3, h = u / 9, sl = u % 9, g = lane >> 4, c = lane & 15;
    LAS unsigned short* CT = (LAS unsigned short*)(lds + (wave >> 2) * 4096);
    float* HO = (float*)(p.ws + WS_HO); float* HDEN = (float*)(p.ws + WS_HDEN);
    const int offA = (16 * wi + c) * 64 + 8 * g, offV = (16 * sl + c) * 64 + 8 * g;
    *(LAS v2u*)(CT + c * 64 + 16 * wi + 4 * g) = (v2u){0u, 0u};
    pg8::f32x4 Cacc = {0.f, 0.f, 0.f, 0.f};
    __syncthreads();
    MlFrags F0, F1;
    ml_load(F0, p, h, offA, offV);
#define ML_STEP(F, n_) do { const int cur = (n_) & 1; \
        const bf16x8_t c0 = *(const LAS bf16x8_t*)(CT + cur * 1024 + c * 64 + 8 * g), c1 = *(const LAS bf16x8_t*)(CT + cur * 1024 + c * 64 + 32 + 8 * g); \
        pg8::f32x4 num = {0.f, 0.f, 0.f, 0.f}; \
        num = __builtin_amdgcn_mfma_f32_16x16x32_bf16(F.q[0], c0, num, 0, 0, 0); num = __builtin_amdgcn_mfma_f32_16x16x32_bf16(F.q[1], c1, num, 0, 0, 0); \
        num = __builtin_amdgcn_mfma_f32_16x16x32_bf16(F.s[0], F.vt[0], num, 0, 0, 0); num = __builtin_amdgcn_mfma_f32_16x16x32_bf16(F.s[1], F.vt[1], num, 0, 0, 0); \
        Cacc = Cacc * F.fl; \
        Cacc = __builtin_amdgcn_mfma_f32_16x16x32_bf16(F.kt[0], F.vt[0], Cacc, 0, 0, 0); Cacc = __builtin_amdgcn_mfma_f32_16x16x32_bf16(F.kt[1], F.vt[1], Cacc, 0, 0, 0); \
        { v2u w; w.x = pk2(Cacc[0], Cacc[1]); w.y = pk2(Cacc[2], Cacc[3]); *(LAS v2u*)(CT + (cur ^ 1) * 1024 + c * 64 + 16 * wi + 4 * g) = w; } \
        { const size_t tb = (size_t)(n_) * 64 + 16 * wi + 4 * g; \
          if (sl < 8) { _Pragma("unroll") for (int r = 0; r < 4; ++r) HO[(tb + r) * BW + h * 128 + 16 * sl + c] = num[r]; } \
          else if (c == 0) { _Pragma("unroll") for (int r = 0; r < 4; ++r) HDEN[(tb + r) * 4 + h] = num[r]; } } \
        LDS_BAR(); } while (0)
    for (int n = 0; n < T / 64; n += 2) {
        ml_load(F1, p, (n + 1) * 4 + h, offA, offV);
        ML_STEP(F0, n);
        ml_load(F0, p, ((n + 2 < T / 64) ? n + 2 : n) * 4 + h, offA, offV);
        ML_STEP(F1, n + 1);
    }
#undef ML_STEP
}


constexpr int QP = 132;
__device__ __forceinline__ void gdn_pre_item(const Params& p, int l, LAS unsigned char* lds, int item, int tid, int wave, int lane) {
    const int h = item & 3, n = item >> 2; const size_t t0 = (size_t)n * 64;
    const bf16* Z = (const bf16*)(p.ws + WS_Z); const float* SMALL = (const float*)(p.ws + WS_SMALL);
    float* GU = (float*)(p.ws + WS_GU) + (size_t)item * 8192; bf16* GNW = (bf16*)(p.ws + WS_GNW) + (size_t)item * 8192; bf16* GQG = (bf16*)(p.ws + WS_GQG) + (size_t)item * 8192;
    bf16* GAT = (bf16*)(p.ws + WS_GAT) + (size_t)item * 4096; bf16* GKT = (bf16*)(p.ws + WS_GKT) + (size_t)item * 8192; float* GDL = (float*)(p.ws + WS_GDL);
    const float* cw = p.in[I_CONVW] + (size_t)l * 4 * 1536;
    LAS float* qs = (LAS float*)lds; LAS float* ks = qs + 64 * QP; LAS float* vs = ks + 64 * QP; LAS float* Ls = vs + 64 * QP;   LAS float* gcs = Ls + 64 * 68; LAS float* bts = gcs + 64; LAS float* btg = bts + 64;
    { const int tk = tid >> 3, part = tid & 7;
#pragma unroll 1
      for (int i = 0; i < 3; ++i) { float a[16];
#pragma unroll
        for (int x = 0; x < 16; ++x) a[x] = 0.f;
#pragma unroll
        for (int j = 0; j < 4; ++j) { const long tt = (long)t0 + tk - 3 + j; if (tt >= 0) {
            const bf16* src = Z + (size_t)tt * ZC + ZC_GDN + i * 512 + h * 128 + 16 * part; float x0[8], x1[8]; unpack8(*(const v4u*)src, x0); unpack8(*(const v4u*)(src + 8), x1);
            const float* wp = cw + j * 1536 + i * 512 + h * 128 + 16 * part;
#pragma unroll
            for (int x = 0; x < 8; ++x) { a[x] += wp[x] * x0[x]; a[8 + x] += wp[8 + x] * x1[x]; } } }
        float ss = 0.f;
#pragma unroll
        for (int x = 0; x < 16; ++x) { a[x] = siluf_(a[x]); ss += a[x] * a[x]; }
        if (i < 2) { ss = sum8(ss); const float r = rsqrtf(ss + 1e-6f) * (i == 0 ? 0.08838834764831845f : 1.f);
#pragma unroll
            for (int x = 0; x < 16; ++x) a[x] *= r; }
        LAS float* dst = (i == 0 ? qs : (i == 1 ? ks : vs)) + tk * QP + 16 * part;
#pragma unroll
        for (int x4 = 0; x4 < 4; ++x4) *(LAS v4f*)(dst + 4 * x4) = (v4f){a[4 * x4], a[4 * x4 + 1], a[4 * x4 + 2], a[4 * x4 + 3]}; } }
    if (wave == 0) { const float bb = SMALL[(t0 + lane) * 16 + h], aa = SMALL[(t0 + lane) * 16 + 4 + h];
        const float g = -__expf(p.in[I_ALOG][l * 4 + h]) * softplusf_(aa + p.in[I_DTB][l * 4 + h]);
        const float gc = wave_scan_incl(g), bt = sigmoidf_(bb); gcs[lane] = gc; bts[lane] = bt; btg[lane] = bt * __expf(gc); }
    __syncthreads();
    { const int i = tid >> 3, jb = tid & 7; const float gi = gcs[i], bi = bts[i]; float dk[8], dq[8];
#pragma unroll
      for (int x = 0; x < 8; ++x) { dk[x] = 0.f; dq[x] = 0.f; }
      if (8 * jb <= i) {
#pragma unroll 2
          for (int d4 = 0; d4 < 32; ++d4) { const v4f qi = *(const LAS v4f*)(qs + i * QP + 4 * d4), ki = *(const LAS v4f*)(ks + i * QP + 4 * d4);
#pragma unroll
              for (int x = 0; x < 8; ++x) { const v4f kj = *(const LAS v4f*)(ks + (8 * jb + x) * QP + 4 * d4);
                  dk[x] += ki.x * kj.x + ki.y * kj.y + ki.z * kj.z + ki.w * kj.w; dq[x] += qi.x * kj.x + qi.y * kj.y + qi.z * kj.z + qi.w * kj.w; } }
#pragma unroll
          for (int x = 0; x < 8; ++x) { const int j = 8 * jb + x; const float dc = __expf(gi - gcs[j]); dk[x] = (j < i) ? bi * dk[x] * dc : 0.f; dq[x] = (j <= i) ? dq[x] * dc : 0.f; } }
      *(LAS v4f*)(Ls + i * 68 + 8 * jb) = (v4f){dk[0], dk[1], dk[2], dk[3]}; *(LAS v4f*)(Ls + i * 68 + 8 * jb + 4) = (v4f){dk[4], dk[5], dk[6], dk[7]};
      v4u w; w.x = pk2(dq[0], dq[1]); w.y = pk2(dq[2], dq[3]); w.z = pk2(dq[4], dq[5]); w.w = pk2(dq[6], dq[7]); *(v4u*)(GAT + i * 64 + 8 * jb) = w; }
    __syncthreads();
    if (tid < 256) {
        const int c = tid; int vz; asm volatile("v_mov_b32 %0, 0" : "=v"(vz));
        const LAS float* rp = (c < 128) ? (vs + c) : (ks + (c - 128)); const LAS float* mp = ((c < 128) ? bts : btg) + vz;
#define GDN_RHS(i) (rp[(i) * QP] * mp[(i)])
#define GDN_L4(i, j4) (*(const LAS v4f*)(Ls + (i) * 68 + 4 * (j4) + vz))
        float x0 = GDN_RHS(0); __builtin_amdgcn_sched_barrier(0);
        float x1 = GDN_RHS(1); { const v4f l = GDN_L4(1, 0); x1 -= l.x * x0; } __builtin_amdgcn_sched_barrier(0);
        float x2 = GDN_RHS(2); { const v4f l = GDN_L4(2, 0); x2 -= l.x * x0; x2 -= l.y * x1; } __builtin_amdgcn_sched_barrier(0);
        float x3 = GDN_RHS(3); { const v4f l = GDN_L4(3, 0); x3 -= l.x * x0; x3 -= l.y * x1; x3 -= l.z * x2; } __builtin_amdgcn_sched_barrier(0);
        float x4 = GDN_RHS(4); { const v4f l = GDN_L4(4, 0); x4 -= l.x * x0; x4 -= l.y * x1; x4 -= l.z * x2; x4 -= l.w * x3; } __builtin_amdgcn_sched_barrier(0);
        float x5 = GDN_RHS(5); { const v4f l = GDN_L4(5, 0); x5 -= l.x * x0; x5 -= l.y * x1; x5 -= l.z * x2; x5 -= l.w * x3; } { const v4f l = GDN_L4(5, 1); x5 -= l.x * x4; } __builtin_amdgcn_sched_barrier(0);
        float x6 = GDN_RHS(6); { const v4f l = GDN_L4(6, 0); x6 -= l.x * x0; x6 -= l.y * x1; x6 -= l.z * x2; x6 -= l.w * x3; } { const v4f l = GDN_L4(6, 1); x6 -= l.x * x4; x6 -= l.y * x5; } __builtin_amdgcn_sched_barrier(0);
        float x7 = GDN_RHS(7); { const v4f l = GDN_L4(7, 0); x7 -= l.x * x0; x7 -= l.y * x1; x7 -= l.z * x2; x7 -= l.w * x3; } { const v4f l = GDN_L4(7, 1); x7 -= l.x * x4; x7 -= l.y * x5; x7 -= l.z * x6; } __builtin_amdgcn_sched_barrier(0);
        float x8 = GDN_RHS(8); { const v4f l = GDN_L4(8, 0); x8 -= l.x * x0; x8 -= l.y * x1; x8 -= l.z * x2; x8 -= l.w * x3; } { const v4f l = GDN_L4(8, 1); x8 -= l.x * x4; x8 -= l.y * x5; x8 -= l.z * x6; x8 -= l.w * x7; } __builtin_amdgcn_sched_barrier(0);
        float x9 = GDN_RHS(9); { const v4f l = GDN_L4(9, 0); x9 -= l.x * x0; x9 -= l.y * x1; x9 -= l.z * x2; x9 -= l.w * x3; } { const v4f l = GDN_L4(9, 1); x9 -= l.x * x4; x9 -= l.y * x5; x9 -= l.z * x6; x9 -= l.w * x7; } { const v4f l = GDN_L4(9, 2); x9 -= l.x * x8; } __builtin_amdgcn_sched_barrier(0);
        float x10 = GDN_RHS(10); { const v4f l = GDN_L4(10, 0); x10 -= l.x * x0; x10 -= l.y * x1; x10 -= l.z * x2; x10 -= l.w * x3; } { const v4f l = GDN_L4(10, 1); x10 -= l.x * x4; x10 -= l.y * x5; x10 -= l.z * x6; x10 -= l.w * x7; } { const v4f l = GDN_L4(10, 2); x10 -= l.x * x8; x10 -= l.y * x9; } __builtin_amdgcn_sched_barrier(0);
        float x11 = GDN_RHS(11); { const v4f l = GDN_L4(11, 0); x11 -= l.x * x0; x11 -= l.y * x1; x11 -= l.z * x2; x11 -= l.w * x3; } { const v4f l = GDN_L4(11, 1); x11 -= l.x * x4; x11 -= l.y * x5; x11 -= l.z * x6; x11 -= l.w * x7; } { const v4f l = GDN_L4(11, 2); x11 -= l.x * x8; x11 -= l.y * x9; x11 -= l.z * x10; } __builtin_amdgcn_sched_barrier(0);
        float x12 = GDN_RHS(12); { const v4f l = GDN_L4(12, 0); x12 -= l.x * x0; x12 -= l.y * x1; x12 -= l.z * x2; x12 -= l.w * x3; } { const v4f l = GDN_L4(12, 1); x12 -= l.x * x4; x12 -= l.y * x5; x12 -= l.z * x6; x12 -= l.w * x7; } { const v4f l = GDN_L4(12, 2); x12 -= l.x * x8; x12 -= l.y * x9; x12 -= l.z * x10; x12 -= l.w * x11; } __builtin_amdgcn_sched_barrier(0);
        float x13 = GDN_RHS(13); { const v4f l = GDN_L4(13, 0); x13 -= l.x * x0; x13 -= l.y * x1; x13 -= l.z * x2; x13 -= l.w * x3; } { const v4f l = GDN_L4(13, 1); x13 -= l.x * x4; x13 -= l.y * x5; x13 -= l.z * x6; x13 -= l.w * x7; } { const v4f l = GDN_L4(13, 2); x13 -= l.x * x8; x13 -= l.y * x9; x13 -= l.z * x10; x13 -= l.w * x11; } { const v4f l = GDN_L4(13, 3); x13 -= l.x * x12; } __builtin_amdgcn_sched_barrier(0);
        float x14 = GDN_RHS(14); { const v4f l = GDN_L4(14, 0); x14 -= l.x * x0; x14 -= l.y * x1; x14 -= l.z * x2; x14 -= l.w * x3; } { const v4f l = GDN_L4(14, 1); x14 -= l.x * x4; x14 -= l.y * x5; x14 -= l.z * x6; x14 -= l.w * x7; } { const v4f l = GDN_L4(14, 2); x14 -= l.x * x8; x14 -= l.y * x9; x14 -= l.z * x10; x14 -= l.w * x11; } { const v4f l = GDN_L4(14, 3); x14 -= l.x * x12; x14 -= l.y * x13; } __builtin_amdgcn_sched_barrier(0);
        float x15 = GDN_RHS(15); { const v4f l = GDN_L4(15, 0); x15 -= l.x * x0; x15 -= l.y * x1; x15 -= l.z * x2; x15 -= l.w * x3; } { const v4f l = GDN_L4(15, 1); x15 -= l.x * x4; x15 -= l.y * x5; x15 -= l.z * x6; x15 -= l.w * x7; } { const v4f l = GDN_L4(15, 2); x15 -= l.x * x8; x15 -= l.y * x9; x15 -= l.z * x10; x15 -= l.w * x11; } { const v4f l = GDN_L4(15, 3); x15 -= l.x * x12; x15 -= l.y * x13; x15 -= l.z * x14; } __builtin_amdgcn_sched_barrier(0);
        float x16 = GDN_RHS(16); { const v4f l = GDN_L4(16, 0); x16 -= l.x * x0; x16 -= l.y * x1; x16 -= l.z * x2; x16 -= l.w * x3; } { const v4f l = GDN_L4(16, 1); x16 -= l.x * x4; x16 -= l.y * x5; x16 -= l.z * x6; x16 -= l.w * x7; } { const v4f l = GDN_L4(16, 2); x16 -= l.x * x8; x16 -= l.y * x9; x16 -= l.z * x10; x16 -= l.w * x11; } { const v4f l = GDN_L4(16, 3); x16 -= l.x * x12; x16 -= l.y * x13; x16 -= l.z * x14; x16 -= l.w * x15; } __builtin_amdgcn_sched_barrier(0);
        float x17 = GDN_RHS(17); { const v4f l = GDN_L4(17, 0); x17 -= l.x * x0; x17 -= l.y * x1; x17 -= l.z * x2; x17 -= l.w * x3; } { const v4f l = GDN_L4(17, 1); x17 -= l.x * x4; x17 -= l.y * x5; x17 -= l.z * x6; x17 -= l.w * x7; } { const v4f l = GDN_L4(17, 2); x17 -= l.x * x8; x17 -= l.y * x9; x17 -= l.z * x10; x17 -= l.w * x11; } { const v4f l = GDN_L4(17, 3); x17 -= l.x * x12; x17 -= l.y * x13; x17 -= l.z * x14; x17 -= l.w * x15; } { const v4f l = GDN_L4(17, 4); x17 -= l.x * x16; } __builtin_amdgcn_sched_barrier(0);
        float x18 = GDN_RHS(18); { const v4f l = GDN_L4(18, 0); x18 -= l.x * x0; x18 -= l.y * x1; x18 -= l.z * x2; x18 -= l.w * x3; } { const v4f l = GDN_L4(18, 1); x18 -= l.x * x4; x18 -= l.y * x5; x18 -= l.z * x6; x18 -= l.w * x7; } { const v4f l = GDN_L4(18, 2); x18 -= l.x * x8; x18 -= l.y * x9; x18 -= l.z * x10; x18 -= l.w * x11; } { const v4f l = GDN_L4(18, 3); x18 -= l.x * x12; x18 -= l.y * x13; x18 -= l.z * x14; x18 -= l.w * x15; } { const v4f l = GDN_L4(18, 4); x18 -= l.x * x16; x18 -= l.y * x17; } __builtin_amdgcn_sched_barrier(0);
        float x19 = GDN_RHS(19); { const v4f l = GDN_L4(19, 0); x19 -= l.x * x0; x19 -= l.y * x1; x19 -= l.z * x2; x19 -= l.w * x3; } { const v4f l = GDN_L4(19, 1); x19 -= l.x * x4; x19 -= l.y * x5; x19 -= l.z * x6; x19 -= l.w * x7; } { const v4f l = GDN_L4(19, 2); x19 -= l.x * x8; x19 -= l.y * x9; x19 -= l.z * x10; x19 -= l.w * x11; } { const v4f l = GDN_L4(19, 3); x19 -= l.x * x12; x19 -= l.y * x13; x19 -= l.z * x14; x19 -= l.w * x15; } { const v4f l = GDN_L4(19, 4); x19 -= l.x * x16; x19 -= l.y * x17; x19 -= l.z * x18; } __builtin_amdgcn_sched_barrier(0);
        float x20 = GDN_RHS(20); { const v4f l = GDN_L4(20, 0); x20 -= l.x * x0; x20 -= l.y * x1; x20 -= l.z * x2; x20 -= l.w * x3; } { const v4f l = GDN_L4(20, 1); x20 -= l.x * x4; x20 -= l.y * x5; x20 -= l.z * x6; x20 -= l.w * x7; } { const v4f l = GDN_L4(20, 2); x20 -= l.x * x8; x20 -= l.y * x9; x20 -= l.z * x10; x20 -= l.w * x11; } { const v4f l = GDN_L4(20, 3); x20 -= l.x * x12; x20 -= l.y * x13; x20 -= l.z * x14; x20 -= l.w * x15; } { const v4f l = GDN_L4(20, 4); x20 -= l.x * x16; x20 -= l.y * x17; x20 -= l.z * x18; x20 -= l.w * x19; } __builtin_amdgcn_sched_barrier(0);
        float x21 = GDN_RHS(21); { const v4f l = GDN_L4(21, 0); x21 -= l.x * x0; x21 -= l.y * x1; x21 -= l.z * x2; x21 -= l.w * x3; } { const v4f l = GDN_L4(21, 1); x21 -= l.x * x4; x21 -= l.y * x5; x21 -= l.z * x6; x21 -= l.w * x7; } { const v4f l = GDN_L4(21, 2); x21 -= l.x * x8; x21 -= l.y * x9; x21 -= l.z * x10; x21 -= l.w * x11; } { const v4f l = GDN_L4(21, 3); x21 -= l.x * x12; x21 -= l.y * x13; x21 -= l.z * x14; x21 -= l.w * x15; } { const v4f l = GDN_L4(21, 4); x21 -= l.x * x16; x21 -= l.y * x17; x21 -= l.z * x18; x21 -= l.w * x19; } { const v4f l = GDN_L4(21, 5); x21 -= l.x * x20; } __builtin_amdgcn_sched_barrier(0);
        float x22 = GDN_RHS(22); { const v4f l = GDN_L4(22, 0); x22 -= l.x * x0; x22 -= l.y * x1; x22 -= l.z * x2; x22 -= l.w * x3; } { const v4f l = GDN_L4(22, 1); x22 -= l.x * x4; x22 -= l.y * x5; x22 -= l.z * x6; x22 -= l.w * x7; } { const v4f l = GDN_L4(22, 2); x22 -= l.x * x8; x22 -= l.y * x9; x22 -= l.z * x10; x22 -= l.w * x11; } { const v4f l = GDN_L4(22, 3); x22 -= l.x * x12; x22 -= l.y * x13; x22 -= l.z * x14; x22 -= l.w * x15; } { const v4f l = GDN_L4(22, 4); x22 -= l.x * x16; x22 -= l.y * x17; x22 -= l.z * x18; x22 -= l.w * x19; } { const v4f l = GDN_L4(22, 5); x22 -= l.x * x20; x22 -= l.y * x21; } __builtin_amdgcn_sched_barrier(0);
        float x23 = GDN_RHS(23); { const v4f l = GDN_L4(23, 0); x23 -= l.x * x0; x23 -= l.y * x1; x23 -= l.z * x2; x23 -= l.w * x3; } { const v4f l = GDN_L4(23, 1); x23 -= l.x * x4; x23 -= l.y * x5; x23 -= l.z * x6; x23 -= l.w * x7; } { const v4f l = GDN_L4(23, 2); x23 -= l.x * x8; x23 -= l.y * x9; x23 -= l.z * x10; x23 -= l.w * x11; } { const v4f l = GDN_L4(23, 3); x23 -= l.x * x12; x23 -= l.y * x13; x23 -= l.z * x14; x23 -= l.w * x15; } { const v4f l = GDN_L4(23, 4); x23 -= l.x * x16; x23 -= l.y * x17; x23 -= l.z * x18; x23 -= l.w * x19; } { const v4f l = GDN_L4(23, 5); x23 -= l.x * x20; x23 -= l.y * x21; x23 -= l.z * x22; } __builtin_amdgcn_sched_barrier(0);
        float x24 = GDN_RHS(24); { const v4f l = GDN_L4(24, 0); x24 -= l.x * x0; x24 -= l.y * x1; x24 -= l.z * x2; x24 -= l.w * x3; } { const v4f l = GDN_L4(24, 1); x24 -= l.x * x4; x24 -= l.y * x5; x24 -= l.z * x6; x24 -= l.w * x7; } { const v4f l = GDN_L4(24, 2); x24 -= l.x * x8; x24 -= l.y * x9; x24 -= l.z * x10; x24 -= l.w * x11; } { const v4f l = GDN_L4(24, 3); x24 -= l.x * x12; x24 -= l.y * x13; x24 -= l.z * x14; x24 -= l.w * x15; } { const v4f l = GDN_L4(24, 4); x24 -= l.x * x16; x24 -= l.y * x17; x24 -= l.z * x18; x24 -= l.w * x19; } { const v4f l = GDN_L4(24, 5); x24 -= l.x * x20; x24 -= l.y * x21; x24 -= l.z * x22; x24 -= l.w * x23; } __builtin_amdgcn_sched_barrier(0);
        float x25 = GDN_RHS(25); { const v4f l = GDN_L4(25, 0); x25 -= l.x * x0; x25 -= l.y * x1; x25 -= l.z * x2; x25 -= l.w * x3; } { const v4f l = GDN_L4(25, 1); x25 -= l.x * x4; x25 -= l.y * x5; x25 -= l.z * x6; x25 -= l.w * x7; } { const v4f l = GDN_L4(25, 2); x25 -= l.x * x8; x25 -= l.y * x9; x25 -= l.z * x10; x25 -= l.w * x11; } { const v4f l = GDN_L4(25, 3); x25 -= l.x * x12; x25 -= l.y * x13; x25 -= l.z * x14; x25 -= l.w * x15; } { const v4f l = GDN_L4(25, 4); x25 -= l.x * x16; x25 -= l.y * x17; x25 -= l.z * x18; x25 -= l.w * x19; } { const v4f l = GDN_L4(25, 5); x25 -= l.x * x20; x25 -= l.y * x21; x25 -= l.z * x22; x25 -= l.w * x23; } { const v4f l = GDN_L4(25, 6); x25 -= l.x * x24; } __builtin_amdgcn_sched_barrier(0);
        float x26 = GDN_RHS(26); { const v4f l = GDN_L4(26, 0); x26 -= l.x * x0; x26 -= l.y * x1; x26 -= l.z * x2; x26 -= l.w * x3; } { const v4f l = GDN_L4(26, 1); x26 -= l.x * x4; x26 -= l.y * x5; x26 -= l.z * x6; x26 -= l.w * x7; } { const v4f l = GDN_L4(26, 2); x26 -= l.x * x8; x26 -= l.y * x9; x26 -= l.z * x10; x26 -= l.w * x11; } { const v4f l = GDN_L4(26, 3); x26 -= l.x * x12; x26 -= l.y * x13; x26 -= l.z * x14; x26 -= l.w * x15; } { const v4f l = GDN_L4(26, 4); x26 -= l.x * x16; x26 -= l.y * x17; x26 -= l.z * x18; x26 -= l.w * x19; } { const v4f l = GDN_L4(26, 5); x26 -= l.x * x20; x26 -= l.y * x21; x26 -= l.z * x22; x26 -= l.w * x23; } { const v4f l = GDN_L4(26, 6); x26 -= l.x * x24; x26 -= l.y * x25; } __builtin_amdgcn_sched_barrier(0);
        float x27 = GDN_RHS(27); { const v4f l = GDN_L4(27, 0); x27 -= l.x * x0; x27 -= l.y * x1; x27 -= l.z * x2; x27 -= l.w * x3; } { const v4f l = GDN_L4(27, 1); x27 -= l.x * x4; x27 -= l.y * x5; x27 -= l.z * x6; x27 -= l.w * x7; } { const v4f l = GDN_L4(27, 2); x27 -= l.x * x8; x27 -= l.y * x9; x27 -= l.z * x10; x27 -= l.w * x11; } { const v4f l = GDN_L4(27, 3); x27 -= l.x * x12; x27 -= l.y * x13; x27 -= l.z * x14; x27 -= l.w * x15; } { const v4f l = GDN_L4(27, 4); x27 -= l.x * x16; x27 -= l.y * x17; x27 -= l.z * x18; x27 -= l.w * x19; } { const v4f l = GDN_L4(27, 5); x27 -= l.x * x20; x27 -= l.y * x21; x27 -= l.z * x22; x27 -= l.w * x23; } { const v4f l = GDN_L4(27, 6); x27 -= l.x * x24; x27 -= l.y * x25; x27 -= l.z * x26; } __builtin_amdgcn_sched_barrier(0);
        float x28 = GDN_RHS(28); { const v4f l = GDN_L4(28, 0); x28 -= l.x * x0; x28 -= l.y * x1; x28 -= l.z * x2; x28 -= l.w * x3; } { const v4f l = GDN_L4(28, 1); x28 -= l.x * x4; x28 -= l.y * x5; x28 -= l.z * x6; x28 -= l.w * x7; } { const v4f l = GDN_L4(28, 2); x28 -= l.x * x8; x28 -= l.y * x9; x28 -= l.z * x10; x28 -= l.w * x11; } { const v4f l = GDN_L4(28, 3); x28 -= l.x * x12; x28 -= l.y * x13; x28 -= l.z * x14; x28 -= l.w * x15; } { const v4f l = GDN_L4(28, 4); x28 -= l.x * x16; x28 -= l.y * x17; x28 -= l.z * x18; x28 -= l.w * x19; } { const v4f l = GDN_L4(28, 5); x28 -= l.x * x20; x28 -= l.y * x21; x28 -= l.z * x22; x28 -= l.w * x23; } { const v4f l = GDN_L4(28, 6); x28 -= l.x * x24; x28 -= l.y * x25; x28 -= l.z * x26; x28 -= l.w * x27; } __builtin_amdgcn_sched_barrier(0);
        float x29 = GDN_RHS(29); { const v4f l = GDN_L4(29, 0); x29 -= l.x * x0; x29 -= l.y * x1; x29 -= l.z * x2; x29 -= l.w * x3; } { const v4f l = GDN_L4(29, 1); x29 -= l.x * x4; x29 -= l.y * x5; x29 -= l.z * x6; x29 -= l.w * x7; } { const v4f l = GDN_L4(29, 2); x29 -= l.x * x8; x29 -= l.y * x9; x29 -= l.z * x10; x29 -= l.w * x11; } { const v4f l = GDN_L4(29, 3); x29 -= l.x * x12; x29 -= l.y * x13; x29 -= l.z * x14; x29 -= l.w * x15; } { const v4f l = GDN_L4(29, 4); x29 -= l.x * x16; x29 -= l.y * x17; x29 -= l.z * x18; x29 -= l.w * x19; } { const v4f l = GDN_L4(29, 5); x29 -= l.x * x20; x29 -= l.y * x21; x29 -= l.z * x22; x29 -= l.w * x23; } { const v4f l = GDN_L4(29, 6); x29 -= l.x * x24; x29 -= l.y * x25; x29 -= l.z * x26; x29 -= l.w * x27; } { const v4f l = GDN_L4(29, 7); x29 -= l.x * x28; } __builtin_amdgcn_sched_barrier(0);
        float x30 = GDN_RHS(30); { const v4f l = GDN_L4(30, 0); x30 -= l.x * x0; x30 -= l.y * x1; x30 -= l.z * x2; x30 -= l.w * x3; } { const v4f l = GDN_L4(30, 1); x30 -= l.x * x4; x30 -= l.y * x5; x30 -= l.z * x6; x30 -= l.w * x7; } { const v4f l = GDN_L4(30, 2); x30 -= l.x * x8; x30 -= l.y * x9; x30 -= l.z * x10; x30 -= l.w * x11; } { const v4f l = GDN_L4(30, 3); x30 -= l.x * x12; x30 -= l.y * x13; x30 -= l.z * x14; x30 -= l.w * x15; } { const v4f l = GDN_L4(30, 4); x30 -= l.x * x16; x30 -= l.y * x17; x30 -= l.z * x18; x30 -= l.w * x19; } { const v4f l = GDN_L4(30, 5); x30 -= l.x * x20; x30 -= l.y * x21; x30 -= l.z * x22; x30 -= l.w * x23; } { const v4f l = GDN_L4(30, 6); x30 -= l.x * x24; x30 -= l.y * x25; x30 -= l.z * x26; x30 -= l.w * x27; } { const v4f l = GDN_L4(30, 7); x30 -= l.x * x28; x30 -= l.y * x29; } __builtin_amdgcn_sched_barrier(0);
        float x31 = GDN_RHS(31); { const v4f l = GDN_L4(31, 0); x31 -= l.x * x0; x31 -= l.y * x1; x31 -= l.z * x2; x31 -= l.w * x3; } { const v4f l = GDN_L4(31, 1); x31 -= l.x * x4; x31 -= l.y * x5; x31 -= l.z * x6; x31 -= l.w * x7; } { const v4f l = GDN_L4(31, 2); x31 -= l.x * x8; x31 -= l.y * x9; x31 -= l.z * x10; x31 -= l.w * x11; } { const v4f l = GDN_L4(31, 3); x31 -= l.x * x12; x31 -= l.y * x13; x31 -= l.z * x14; x31 -= l.w * x15; } { const v4f l = GDN_L4(31, 4); x31 -= l.x * x16; x31 -= l.y * x17; x31 -= l.z * x18; x31 -= l.w * x19; } { const v4f l = GDN_L4(31, 5); x31 -= l.x * x20; x31 -= l.y * x21; x31 -= l.z * x22; x31 -= l.w * x23; } { const v4f l = GDN_L4(31, 6); x31 -= l.x * x24; x31 -= l.y * x25; x31 -= l.z * x26; x31 -= l.w * x27; } { const v4f l = GDN_L4(31, 7); x31 -= l.x * x28; x31 -= l.y * x29; x31 -= l.z * x30; } __builtin_amdgcn_sched_barrier(0);
        float x32 = GDN_RHS(32); { const v4f l = GDN_L4(32, 0); x32 -= l.x * x0; x32 -= l.y * x1; x32 -= l.z * x2; x32 -= l.w * x3; } { const v4f l = GDN_L4(32, 1); x32 -= l.x * x4; x32 -= l.y * x5; x32 -= l.z * x6; x32 -= l.w * x7; } { const v4f l = GDN_L4(32, 2); x32 -= l.x * x8; x32 -= l.y * x9; x32 -= l.z * x10; x32 -= l.w * x11; } { const v4f l = GDN_L4(32, 3); x32 -= l.x * x12; x32 -= l.y * x13; x32 -= l.z * x14; x32 -= l.w * x15; } { const v4f l = GDN_L4(32, 4); x32 -= l.x * x16; x32 -= l.y * x17; x32 -= l.z * x18; x32 -= l.w * x19; } { const v4f l = GDN_L4(32, 5); x32 -= l.x * x20; x32 -= l.y * x21; x32 -= l.z * x22; x32 -= l.w * x23; } { const v4f l = GDN_L4(32, 6); x32 -= l.x * x24; x32 -= l.y * x25; x32 -= l.z * x26; x32 -= l.w * x27; } { const v4f l = GDN_L4(32, 7); x32 -= l.x * x28; x32 -= l.y * x29; x32 -= l.z * x30; x32 -= l.w * x31; } __builtin_amdgcn_sched_barrier(0);
        float x33 = GDN_RHS(33); { const v4f l = GDN_L4(33, 0); x33 -= l.x * x0; x33 -= l.y * x1; x33 -= l.z * x2; x33 -= l.w * x3; } { const v4f l = GDN_L4(33, 1); x33 -= l.x * x4; x33 -= l.y * x5; x33 -= l.z * x6; x33 -= l.w * x7; } { const v4f l = GDN_L4(33, 2); x33 -= l.x * x8; x33 -= l.y * x9; x33 -= l.z * x10; x33 -= l.w * x11; } { const v4f l = GDN_L4(33, 3); x33 -= l.x * x12; x33 -= l.y * x13; x33 -= l.z * x14; x33 -= l.w * x15; } { const v4f l = GDN_L4(33, 4); x33 -= l.x * x16; x33 -= l.y * x17; x33 -= l.z * x18; x33 -= l.w * x19; } { const v4f l = GDN_L4(33, 5); x33 -= l.x * x20; x33 -= l.y * x21; x33 -= l.z * x22; x33 -= l.w * x23; } { const v4f l = GDN_L4(33, 6); x33 -= l.x * x24; x33 -= l.y * x25; x33 -= l.z * x26; x33 -= l.w * x27; } { const v4f l = GDN_L4(33, 7); x33 -= l.x * x28; x33 -= l.y * x29; x33 -= l.z * x30; x33 -= l.w * x31; } { const v4f l = GDN_L4(33, 8); x33 -= l.x * x32; } __builtin_amdgcn_sched_barrier(0);
        float x34 = GDN_RHS(34); { const v4f l = GDN_L4(34, 0); x34 -= l.x * x0; x34 -= l.y * x1; x34 -= l.z * x2; x34 -= l.w * x3; } { const v4f l = GDN_L4(34, 1); x34 -= l.x * x4; x34 -= l.y * x5; x34 -= l.z * x6; x34 -= l.w * x7; } { const v4f l = GDN_L4(34, 2); x34 -= l.x * x8; x34 -= l.y * x9; x34 -= l.z * x10; x34 -= l.w * x11; } { const v4f l = GDN_L4(34, 3); x34 -= l.x * x12; x34 -= l.y * x13; x34 -= l.z * x14; x34 -= l.w * x15; } { const v4f l = GDN_L4(34, 4); x34 -= l.x * x16; x34 -= l.y * x17; x34 -= l.z * x18; x34 -= l.w * x19; } { const v4f l = GDN_L4(34, 5); x34 -= l.x * x20; x34 -= l.y * x21; x34 -= l.z * x22; x34 -= l.w * x23; } { const v4f l = GDN_L4(34, 6); x34 -= l.x * x24; x34 -= l.y * x25; x34 -= l.z * x26; x34 -= l.w * x27; } { const v4f l = GDN_L4(34, 7); x34 -= l.x * x28; x34 -= l.y * x29; x34 -= l.z * x30; x34 -= l.w * x31; } { const v4f l = GDN_L4(34, 8); x34 -= l.x * x32; x34 -= l.y * x33; } __builtin_amdgcn_sched_barrier(0);
        float x35 = GDN_RHS(35); { const v4f l = GDN_L4(35, 0); x35 -= l.x * x0; x35 -= l.y * x1; x35 -= l.z * x2; x35 -= l.w * x3; } { const v4f l = GDN_L4(35, 1); x35 -= l.x * x4; x35 -= l.y * x5; x35 -= l.z * x6; x35 -= l.w * x7; } { const v4f l = GDN_L4(35, 2); x35 -= l.x * x8; x35 -= l.y * x9; x35 -= l.z * x10; x35 -= l.w * x11; } { const v4f l = GDN_L4(35, 3); x35 -= l.x * x12; x35 -= l.y * x13; x35 -= l.z * x14; x35 -= l.w * x15; } { const v4f l = GDN_L4(35, 4); x35 -= l.x * x16; x35 -= l.y * x17; x35 -= l.z * x18; x35 -= l.w * x19; } { const v4f l = GDN_L4(35, 5); x35 -= l.x * x20; x35 -= l.y * x21; x35 -= l.z * x22; x35 -= l.w * x23; } { const v4f l = GDN_L4(35, 6); x35 -= l.x * x24; x35 -= l.y * x25; x35 -= l.z * x26; x35 -= l.w * x27; } { const v4f l = GDN_L4(35, 7); x35 -= l.x * x28; x35 -= l.y * x29; x35 -= l.z * x30; x35 -= l.w * x31; } { const v4f l = GDN_L4(35, 8); x35 -= l.x * x32; x35 -= l.y * x33; x35 -= l.z * x34; } __builtin_amdgcn_sched_barrier(0);
        float x36 = GDN_RHS(36); { const v4f l = GDN_L4(36, 0); x36 -= l.x * x0; x36 -= l.y * x1; x36 -= l.z * x2; x36 -= l.w * x3; } { const v4f l = GDN_L4(36, 1); x36 -= l.x * x4; x36 -= l.y * x5; x36 -= l.z * x6; x36 -= l.w * x7; } { const v4f l = GDN_L4(36, 2); x36 -= l.x * x8; x36 -= l.y * x9; x36 -= l.z * x10; x36 -= l.w * x11; } { const v4f l = GDN_L4(36, 3); x36 -= l.x * x12; x36 -= l.y * x13; x36 -= l.z * x14; x36 -= l.w * x15; } { const v4f l = GDN_L4(36, 4); x36 -= l.x * x16; x36 -= l.y * x17; x36 -= l.z * x18; x36 -= l.w * x19; } { const v4f l = GDN_L4(36, 5); x36 -= l.x * x20; x36 -= l.y * x21; x36 -= l.z * x22; x36 -= l.w * x23; } { const v4f l = GDN_L4(36, 6); x36 -= l.x * x24; x36 -= l.y * x25; x36 -= l.z * x26; x36 -= l.w * x27; } { const v4f l = GDN_L4(36, 7); x36 -= l.x * x28; x36 -= l.y * x29; x36 -= l.z * x30; x36 -= l.w * x31; } { const v4f l = GDN_L4(36, 8); x36 -= l.x * x32; x36 -= l.y * x33; x36 -= l.z * x34; x36 -= l.w * x35; } __builtin_amdgcn_sched_barrier(0);
        float x37 = GDN_RHS(37); { const v4f l = GDN_L4(37, 0); x37 -= l.x * x0; x37 -= l.y * x1; x37 -= l.z * x2; x37 -= l.w * x3; } { const v4f l = GDN_L4(37, 1); x37 -= l.x * x4; x37 -= l.y * x5; x37 -= l.z * x6; x37 -= l.w * x7; } { const v4f l = GDN_L4(37, 2); x37 -= l.x * x8; x37 -= l.y * x9; x37 -= l.z * x10; x37 -= l.w * x11; } { const v4f l = GDN_L4(37, 3); x37 -= l.x * x12; x37 -= l.y * x13; x37 -= l.z * x14; x37 -= l.w * x15; } { const v4f l = GDN_L4(37, 4); x37 -= l.x * x16; x37 -= l.y * x17; x37 -= l.z * x18; x37 -= l.w * x19; } { const v4f l = GDN_L4(37, 5); x37 -= l.x * x20; x37 -= l.y * x21; x37 -= l.z * x22; x37 -= l.w * x23; } { const v4f l = GDN_L4(37, 6); x37 -= l.x * x24; x37 -= l.y * x25; x37 -= l.z * x26; x37 -= l.w * x27; } { const v4f l = GDN_L4(37, 7); x37 -= l.x * x28; x37 -= l.y * x29; x37 -= l.z * x30; x37 -= l.w * x31; } { const v4f l = GDN_L4(37, 8); x37 -= l.x * x32; x37 -= l.y * x33; x37 -= l.z * x34; x37 -= l.w * x35; } { const v4f l = GDN_L4(37, 9); x37 -= l.x * x36; } __builtin_amdgcn_sched_barrier(0);
        float x38 = GDN_RHS(38); { const v4f l = GDN_L4(38, 0); x38 -= l.x * x0; x38 -= l.y * x1; x38 -= l.z * x2; x38 -= l.w * x3; } { const v4f l = GDN_L4(38, 1); x38 -= l.x * x4; x38 -= l.y * x5; x38 -= l.z * x6; x38 -= l.w * x7; } { const v4f l = GDN_L4(38, 2); x38 -= l.x * x8; x38 -= l.y * x9; x38 -= l.z * x10; x38 -= l.w * x11; } { const v4f l = GDN_L4(38, 3); x38 -= l.x * x12; x38 -= l.y * x13; x38 -= l.z * x14; x38 -= l.w * x15; } { const v4f l = GDN_L4(38, 4); x38 -= l.x * x16; x38 -= l.y * x17; x38 -= l.z * x18; x38 -= l.w * x19; } { const v4f l = GDN_L4(38, 5); x38 -= l.x * x20; x38 -= l.y * x21; x38 -= l.z * x22; x38 -= l.w * x23; } { const v4f l = GDN_L4(38, 6); x38 -= l.x * x24; x38 -= l.y * x25; x38 -= l.z * x26; x38 -= l.w * x27; } { const v4f l = GDN_L4(38, 7); x38 -= l.x * x28; x38 -= l.y * x29; x38 -= l.z * x30; x38 -= l.w * x31; } { const v4f l = GDN_L4(38, 8); x38 -= l.x * x32; x38 -= l.y * x33; x38 -= l.z * x34; x38 -= l.w * x35; } { const v4f l = GDN_L4(38, 9); x38 -= l.x * x36; x38 -= l.y * x37; } __builtin_amdgcn_sched_barrier(0);
        float x39 = GDN_RHS(39); { const v4f l = GDN_L4(39, 0); x39 -= l.x * x0; x39 -= l.y * x1; x39 -= l.z * x2; x39 -= l.w * x3; } { const v4f l = GDN_L4(39, 1); x39 -= l.x * x4; x39 -= l.y * x5; x39 -= l.z * x6; x39 -= l.w * x7; } { const v4f l = GDN_L4(39, 2); x39 -= l.x * x8; x39 -= l.y * x9; x39 -= l.z * x10; x39 -= l.w * x11; } { const v4f l = GDN_L4(39, 3); x39 -= l.x * x12; x39 -= l.y * x13; x39 -= l.z * x14; x39 -= l.w * x15; } { const v4f l = GDN_L4(39, 4); x39 -= l.x * x16; x39 -= l.y * x17; x39 -= l.z * x18; x39 -= l.w * x19; } { const v4f l = GDN_L4(39, 5); x39 -= l.x * x20; x39 -= l.y * x21; x39 -= l.z * x22; x39 -= l.w * x23; } { const v4f l = GDN_L4(39, 6); x39 -= l.x * x24; x39 -= l.y * x25; x39 -= l.z * x26; x39 -= l.w * x27; } { const v4f l = GDN_L4(39, 7); x39 -= l.x * x28; x39 -= l.y * x29; x39 -= l.z * x30; x39 -= l.w * x31; } { const v4f l = GDN_L4(39, 8); x39 -= l.x * x32; x39 -= l.y * x33; x39 -= l.z * x34; x39 -= l.w * x35; } { const v4f l = GDN_L4(39, 9); x39 -= l.x * x36; x39 -= l.y * x37; x39 -= l.z * x38; } __builtin_amdgcn_sched_barrier(0);
        float x40 = GDN_RHS(40); { const v4f l = GDN_L4(40, 0); x40 -= l.x * x0; x40 -= l.y * x1; x40 -= l.z * x2; x40 -= l.w * x3; } { const v4f l = GDN_L4(40, 1); x40 -= l.x * x4; x40 -= l.y * x5; x40 -= l.z * x6; x40 -= l.w * x7; } { const v4f l = GDN_L4(40, 2); x40 -= l.x * x8; x40 -= l.y * x9; x40 -= l.z * x10; x40 -= l.w * x11; } { const v4f l = GDN_L4(40, 3); x40 -= l.x * x12; x40 -= l.y * x13; x40 -= l.z * x14; x40 -= l.w * x15; } { const v4f l = GDN_L4(40, 4); x40 -= l.x * x16; x40 -= l.y * x17; x40 -= l.z * x18; x40 -= l.w * x19; } { const v4f l = GDN_L4(40, 5); x40 -= l.x * x20; x40 -= l.y * x21; x40 -= l.z * x22; x40 -= l.w * x23; } { const v4f l = GDN_L4(40, 6); x40 -= l.x * x24; x40 -= l.y * x25; x40 -= l.z * x26; x40 -= l.w * x27; } { const v4f l = GDN_L4(40, 7); x40 -= l.x * x28; x40 -= l.y * x29; x40 -= l.z * x30; x40 -= l.w * x31; } { const v4f l = GDN_L4(40, 8); x40 -= l.x * x32; x40 -= l.y * x33; x40 -= l.z * x34; x40 -= l.w * x35; } { const v4f l = GDN_L4(40, 9); x40 -= l.x * x36; x40 -= l.y * x37; x40 -= l.z * x38; x40 -= l.w * x39; } __builtin_amdgcn_sched_barrier(0);
        float x41 = GDN_RHS(41); { const v4f l = GDN_L4(41, 0); x41 -= l.x * x0; x41 -= l.y * x1; x41 -= l.z * x2; x41 -= l.w * x3; } { const v4f l = GDN_L4(41, 1); x41 -= l.x * x4; x41 -= l.y * x5; x41 -= l.z * x6; x41 -= l.w * x7; } { const v4f l = GDN_L4(41, 2); x41 -= l.x * x8; x41 -= l.y * x9; x41 -= l.z * x10; x41 -= l.w * x11; } { const v4f l = GDN_L4(41, 3); x41 -= l.x * x12; x41 -= l.y * x13; x41 -= l.z * x14; x41 -= l.w * x15; } { const v4f l = GDN_L4(41, 4); x41 -= l.x * x16; x41 -= l.y * x17; x41 -= l.z * x18; x41 -= l.w * x19; } { const v4f l = GDN_L4(41, 5); x41 -= l.x * x20; x41 -= l.y * x21; x41 -= l.z * x22; x41 -= l.w * x23; } { const v4f l = GDN_L4(41, 6); x41 -= l.x * x24; x41 -= l.y * x25; x41 -= l.z * x26; x41 -= l.w * x27; } { const v4f l = GDN_L4(41, 7); x41 -= l.x * x28; x41 -= l.y * x29; x41 -= l.z * x30; x41 -= l.w * x31; } { const v4f l = GDN_L4(41, 8); x41 -= l.x * x32; x41 -= l.y * x33; x41 -= l.z * x34; x41 -= l.w * x35; } { const v4f l = GDN_L4(41, 9); x41 -= l.x * x36; x41 -= l.y * x37; x41 -= l.z * x38; x41 -= l.w * x39; } { const v4f l = GDN_L4(41, 10); x41 -= l.x * x40; } __builtin_amdgcn_sched_barrier(0);
        float x42 = GDN_RHS(42); { const v4f l = GDN_L4(42, 0); x42 -= l.x * x0; x42 -= l.y * x1; x42 -= l.z * x2; x42 -= l.w * x3; } { const v4f l = GDN_L4(42, 1); x42 -= l.x * x4; x42 -= l.y * x5; x42 -= l.z * x6; x42 -= l.w * x7; } { const v4f l = GDN_L4(42, 2); x42 -= l.x * x8; x42 -= l.y * x9; x42 -= l.z * x10; x42 -= l.w * x11; } { const v4f l = GDN_L4(42, 3); x42 -= l.x * x12; x42 -= l.y * x13; x42 -= l.z * x14; x42 -= l.w * x15; } { const v4f l = GDN_L4(42, 4); x42 -= l.x * x16; x42 -= l.y * x17; x42 -= l.z * x18; x42 -= l.w * x19; } { const v4f l = GDN_L4(42, 5); x42 -= l.x * x20; x42 -= l.y * x21; x42 -= l.z * x22; x42 -= l.w * x23; } { const v4f l = GDN_L4(42, 6); x42 -= l.x * x24; x42 -= l.y * x25; x42 -= l.z * x26; x42 -= l.w * x27; } { const v4f l = GDN_L4(42, 7); x42 -= l.x * x28; x42 -= l.y * x29; x42 -= l.z * x30; x42 -= l.w * x31; } { const v4f l = GDN_L4(42, 8); x42 -= l.x * x32; x42 -= l.y * x33; x42 -= l.z * x34; x42 -= l.w * x35; } { const v4f l = GDN_L4(42, 9); x42 -= l.x * x36; x42 -= l.y * x37; x42 -= l.z * x38; x42 -= l.w * x39; } { const v4f l = GDN_L4(42, 10); x42 -= l.x * x40; x42 -= l.y * x41; } __builtin_amdgcn_sched_barrier(0);
        float x43 = GDN_RHS(43); { const v4f l = GDN_L4(43, 0); x43 -= l.x * x0; x43 -= l.y * x1; x43 -= l.z * x2; x43 -= l.w * x3; } { const v4f l = GDN_L4(43, 1); x43 -= l.x * x4; x43 -= l.y * x5; x43 -= l.z * x6; x43 -= l.w * x7; } { const v4f l = GDN_L4(43, 2); x43 -= l.x * x8; x43 -= l.y * x9; x43 -= l.z * x10; x43 -= l.w * x11; } { const v4f l = GDN_L4(43, 3); x43 -= l.x * x12; x43 -= l.y * x13; x43 -= l.z * x14; x43 -= l.w * x15; } { const v4f l = GDN_L4(43, 4); x43 -= l.x * x16; x43 -= l.y * x17; x43 -= l.z * x18; x43 -= l.w * x19; } { const v4f l = GDN_L4(43, 5); x43 -= l.x * x20; x43 -= l.y * x21; x43 -= l.z * x22; x43 -= l.w * x23; } { const v4f l = GDN_L4(43, 6); x43 -= l.x * x24; x43 -= l.y * x25; x43 -= l.z * x26; x43 -= l.w * x27; } { const v4f l = GDN_L4(43, 7); x43 -= l.x * x28; x43 -= l.y * x29; x43 -= l.z * x30; x43 -= l.w * x31; } { const v4f l = GDN_L4(43, 8); x43 -= l.x * x32; x43 -= l.y * x33; x43 -= l.z * x34; x43 -= l.w * x35; } { const v4f l = GDN_L4(43, 9); x43 -= l.x * x36; x43 -= l.y * x37; x43 -= l.z * x38; x43 -= l.w * x39; } { const v4f l = GDN_L4(43, 10); x43 -= l.x * x40; x43 -= l.y * x41; x43 -= l.z * x42; } __builtin_amdgcn_sched_barrier(0);
        float x44 = GDN_RHS(44); { const v4f l = GDN_L4(44, 0); x44 -= l.x * x0; x44 -= l.y * x1; x44 -= l.z * x2; x44 -= l.w * x3; } { const v4f l = GDN_L4(44, 1); x44 -= l.x * x4; x44 -= l.y * x5; x44 -= l.z * x6; x44 -= l.w * x7; } { const v4f l = GDN_L4(44, 2); x44 -= l.x * x8; x44 -= l.y * x9; x44 -= l.z * x10; x44 -= l.w * x11; } { const v4f l = GDN_L4(44, 3); x44 -= l.x * x12; x44 -= l.y * x13; x44 -= l.z * x14; x44 -= l.w * x15; } { const v4f l = GDN_L4(44, 4); x44 -= l.x * x16; x44 -= l.y * x17; x44 -= l.z * x18; x44 -= l.w * x19; } { const v4f l = GDN_L4(44, 5); x44 -= l.x * x20; x44 -= l.y * x21; x44 -= l.z * x22; x44 -= l.w * x23; } { const v4f l = GDN_L4(44, 6); x44 -= l.x * x24; x44 -= l.y * x25; x44 -= l.z * x26; x44 -= l.w * x27; } { const v4f l = GDN_L4(44, 7); x44 -= l.x * x28; x44 -= l.y * x29; x44 -= l.z * x30; x44 -= l.w * x31; } { const v4f l = GDN_L4(44, 8); x44 -= l.x * x32; x44 -= l.y * x33; x44 -= l.z * x34; x44 -= l.w * x35; } { const v4f l = GDN_L4(44, 9); x44 -= l.x * x36; x44 -= l.y * x37; x44 -= l.z * x38; x44 -= l.w * x39; } { const v4f l = GDN_L4(44, 10); x44 -= l.x * x40; x44 -= l.y * x41; x44 -= l.z * x42; x44 -= l.w * x43; } __builtin_amdgcn_sched_barrier(0);
        float x45 = GDN_RHS(45); { const v4f l = GDN_L4(45, 0); x45 -= l.x * x0; x45 -= l.y * x1; x45 -= l.z * x2; x45 -= l.w * x3; } { const v4f l = GDN_L4(45, 1); x45 -= l.x * x4; x45 -= l.y * x5; x45 -= l.z * x6; x45 -= l.w * x7; } { const v4f l = GDN_L4(45, 2); x45 -= l.x * x8; x45 -= l.y * x9; x45 -= l.z * x10; x45 -= l.w * x11; } { const v4f l = GDN_L4(45, 3); x45 -= l.x * x12; x45 -= l.y * x13; x45 -= l.z * x14; x45 -= l.w * x15; } { const v4f l = GDN_L4(45, 4); x45 -= l.x * x16; x45 -= l.y * x17; x45 -= l.z * x18; x45 -= l.w * x19; } { const v4f l = GDN_L4(45, 5); x45 -= l.x * x20; x45 -= l.y * x21; x45 -= l.z * x22; x45 -= l.w * x23; } { const v4f l = GDN_L4(45, 6); x45 -= l.x * x24; x45 -= l.y * x25; x45 -= l.z * x26; x45 -= l.w * x27; } { const v4f l = GDN_L4(45, 7); x45 -= l.x * x28; x45 -= l.y * x29; x45 -= l.z * x30; x45 -= l.w * x31; } { const v4f l = GDN_L4(45, 8); x45 -= l.x * x32; x45 -= l.y * x33; x45 -= l.z * x34; x45 -= l.w * x35; } { const v4f l = GDN_L4(45, 9); x45 -= l.x * x36; x45 -= l.y * x37; x45 -= l.z * x38; x45 -= l.w * x39; } { const v4f l = GDN_L4(45, 10); x45 -= l.x * x40; x45 -= l.y * x41; x45 -= l.z * x42; x45 -= l.w * x43; } { const v4f l = GDN_L4(45, 11); x45 -= l.x * x44; } __builtin_amdgcn_sched_barrier(0);
        float x46 = GDN_RHS(46); { const v4f l = GDN_L4(46, 0); x46 -= l.x * x0; x46 -= l.y * x1; x46 -= l.z * x2; x46 -= l.w * x3; } { const v4f l = GDN_L4(46, 1); x46 -= l.x * x4; x46 -= l.y * x5; x46 -= l.z * x6; x46 -= l.w * x7; } { const v4f l = GDN_L4(46, 2); x46 -= l.x * x8; x46 -= l.y * x9; x46 -= l.z * x10; x46 -= l.w * x11; } { const v4f l = GDN_L4(46, 3); x46 -= l.x * x12; x46 -= l.y * x13; x46 -= l.z * x14; x46 -= l.w * x15; } { const v4f l = GDN_L4(46, 4); x46 -= l.x * x16; x46 -= l.y * x17; x46 -= l.z * x18; x46 -= l.w * x19; } { const v4f l = GDN_L4(46, 5); x46 -= l.x * x20; x46 -= l.y * x21; x46 -= l.z * x22; x46 -= l.w * x23; } { const v4f l = GDN_L4(46, 6); x46 -= l.x * x24; x46 -= l.y * x25; x46 -= l.z * x26; x46 -= l.w * x27; } { const v4f l = GDN_L4(46, 7); x46 -= l.x * x28; x46 -= l.y * x29; x46 -= l.z * x30; x46 -= l.w * x31; } { const v4f l = GDN_L4(46, 8); x46 -= l.x * x32; x46 -= l.y * x33; x46 -= l.z * x34; x46 -= l.w * x35; } { const v4f l = GDN_L4(46, 9); x46 -= l.x * x36; x46 -= l.y * x37; x46 -= l.z * x38; x46 -= l.w * x39; } { const v4f l = GDN_L4(46, 10); x46 -= l.x * x40; x46 -= l.y * x41; x46 -= l.z * x42; x46 -= l.w * x43; } { const v4f l = GDN_L4(46, 11); x46 -= l.x * x44; x46 -= l.y * x45; } __builtin_amdgcn_sched_barrier(0);
        float x47 = GDN_RHS(47); { const v4f l = GDN_L4(47, 0); x47 -= l.x * x0; x47 -= l.y * x1; x47 -= l.z * x2; x47 -= l.w * x3; } { const v4f l = GDN_L4(47, 1); x47 -= l.x * x4; x47 -= l.y * x5; x47 -= l.z * x6; x47 -= l.w * x7; } { const v4f l = GDN_L4(47, 2); x47 -= l.x * x8; x47 -= l.y * x9; x47 -= l.z * x10; x47 -= l.w * x11; } { const v4f l = GDN_L4(47, 3); x47 -= l.x * x12; x47 -= l.y * x13; x47 -= l.z * x14; x47 -= l.w * x15; } { const v4f l = GDN_L4(47, 4); x47 -= l.x * x16; x47 -= l.y * x17; x47 -= l.z * x18; x47 -= l.w * x19; } { const v4f l = GDN_L4(47, 5); x47 -= l.x * x20; x47 -= l.y * x21; x47 -= l.z * x22; x47 -= l.w * x23; } { const v4f l = GDN_L4(47, 6); x47 -= l.x * x24; x47 -= l.y * x25; x47 -= l.z * x26; x47 -= l.w * x27; } { const v4f l = GDN_L4(47, 7); x47 -= l.x * x28; x47 -= l.y * x29; x47 -= l.z * x30; x47 -= l.w * x31; } { const v4f l = GDN_L4(47, 8); x47 -= l.x * x32; x47 -= l.y * x33; x47 -= l.z * x34; x47 -= l.w * x35; } { const v4f l = GDN_L4(47, 9); x47 -= l.x * x36; x47 -= l.y * x37; x47 -= l.z * x38; x47 -= l.w * x39; } { const v4f l = GDN_L4(47, 10); x47 -= l.x * x40; x47 -= l.y * x41; x47 -= l.z * x42; x47 -= l.w * x43; } { const v4f l = GDN_L4(47, 11); x47 -= l.x * x44; x47 -= l.y * x45; x47 -= l.z * x46; } __builtin_amdgcn_sched_barrier(0);
        float x48 = GDN_RHS(48); { const v4f l = GDN_L4(48, 0); x48 -= l.x * x0; x48 -= l.y * x1; x48 -= l.z * x2; x48 -= l.w * x3; } { const v4f l = GDN_L4(48, 1); x48 -= l.x * x4; x48 -= l.y * x5; x48 -= l.z * x6; x48 -= l.w * x7; } { const v4f l = GDN_L4(48, 2); x48 -= l.x * x8; x48 -= l.y * x9; x48 -= l.z * x10; x48 -= l.w * x11; } { const v4f l = GDN_L4(48, 3); x48 -= l.x * x12; x48 -= l.y * x13; x48 -= l.z * x14; x48 -= l.w * x15; } { const v4f l = GDN_L4(48, 4); x48 -= l.x * x16; x48 -= l.y * x17; x48 -= l.z * x18; x48 -= l.w * x19; } { const v4f l = GDN_L4(48, 5); x48 -= l.x * x20; x48 -= l.y * x21; x48 -= l.z * x22; x48 -= l.w * x23; } { const v4f l = GDN_L4(48, 6); x48 -= l.x * x24; x48 -= l.y * x25; x48 -= l.z * x26; x48 -= l.w * x27; } { const v4f l = GDN_L4(48, 7); x48 -= l.x * x28; x48 -= l.y * x29; x48 -= l.z * x30; x48 -= l.w * x31; } { const v4f l = GDN_L4(48, 8); x48 -= l.x * x32; x48 -= l.y * x33; x48 -= l.z * x34; x48 -= l.w * x35; } { const v4f l = GDN_L4(48, 9); x48 -= l.x * x36; x48 -= l.y * x37; x48 -= l.z * x38; x48 -= l.w * x39; } { const v4f l = GDN_L4(48, 10); x48 -= l.x * x40; x48 -= l.y * x41; x48 -= l.z * x42; x48 -= l.w * x43; } { const v4f l = GDN_L4(48, 11); x48 -= l.x * x44; x48 -= l.y * x45; x48 -= l.z * x46; x48 -= l.w * x47; } __builtin_amdgcn_sched_barrier(0);
        float x49 = GDN_RHS(49); { const v4f l = GDN_L4(49, 0); x49 -= l.x * x0; x49 -= l.y * x1; x49 -= l.z * x2; x49 -= l.w * x3; } { const v4f l = GDN_L4(49, 1); x49 -= l.x * x4; x49 -= l.y * x5; x49 -= l.z * x6; x49 -= l.w * x7; } { const v4f l = GDN_L4(49, 2); x49 -= l.x * x8; x49 -= l.y * x9; x49 -= l.z * x10; x49 -= l.w * x11; } { const v4f l = GDN_L4(49, 3); x49 -= l.x * x12; x49 -= l.y * x13; x49 -= l.z * x14; x49 -= l.w * x15; } { const v4f l = GDN_L4(49, 4); x49 -= l.x * x16; x49 -= l.y * x17; x49 -= l.z * x18; x49 -= l.w * x19; } { const v4f l = GDN_L4(49, 5); x49 -= l.x * x20; x49 -= l.y * x21; x49 -= l.z * x22; x49 -= l.w * x23; } { const v4f l = GDN_L4(49, 6); x49 -= l.x * x24; x49 -= l.y * x25; x49 -= l.z * x26; x49 -= l.w * x27; } { const v4f l = GDN_L4(49, 7); x49 -= l.x * x28; x49 -= l.y * x29; x49 -= l.z * x30; x49 -= l.w * x31; } { const v4f l = GDN_L4(49, 8); x49 -= l.x * x32; x49 -= l.y * x33; x49 -= l.z * x34; x49 -= l.w * x35; } { const v4f l = GDN_L4(49, 9); x49 -= l.x * x36; x49 -= l.y * x37; x49 -= l.z * x38; x49 -= l.w * x39; } { const v4f l = GDN_L4(49, 10); x49 -= l.x * x40; x49 -= l.y * x41; x49 -= l.z * x42; x49 -= l.w * x43; } { const v4f l = GDN_L4(49, 11); x49 -= l.x * x44; x49 -= l.y * x45; x49 -= l.z * x46; x49 -= l.w * x47; } { const v4f l = GDN_L4(49, 12); x49 -= l.x * x48; } __builtin_amdgcn_sched_barrier(0);
        float x50 = GDN_RHS(50); { const v4f l = GDN_L4(50, 0); x50 -= l.x * x0; x50 -= l.y * x1; x50 -= l.z * x2; x50 -= l.w * x3; } { const v4f l = GDN_L4(50, 1); x50 -= l.x * x4; x50 -= l.y * x5; x50 -= l.z * x6; x50 -= l.w * x7; } { const v4f l = GDN_L4(50, 2); x50 -= l.x * x8; x50 -= l.y * x9; x50 -= l.z * x10; x50 -= l.w * x11; } { const v4f l = GDN_L4(50, 3); x50 -= l.x * x12; x50 -= l.y * x13; x50 -= l.z * x14; x50 -= l.w * x15; } { const v4f l = GDN_L4(50, 4); x50 -= l.x * x16; x50 -= l.y * x17; x50 -= l.z * x18; x50 -= l.w * x19; } { const v4f l = GDN_L4(50, 5); x50 -= l.x * x20; x50 -= l.y * x21; x50 -= l.z * x22; x50 -= l.w * x23; } { const v4f l = GDN_L4(50, 6); x50 -= l.x * x24; x50 -= l.y * x25; x50 -= l.z * x26; x50 -= l.w * x27; } { const v4f l = GDN_L4(50, 7); x50 -= l.x * x28; x50 -= l.y * x29; x50 -= l.z * x30; x50 -= l.w * x31; } { const v4f l = GDN_L4(50, 8); x50 -= l.x * x32; x50 -= l.y * x33; x50 -= l.z * x34; x50 -= l.w * x35; } { const v4f l = GDN_L4(50, 9); x50 -= l.x * x36; x50 -= l.y * x37; x50 -= l.z * x38; x50 -= l.w * x39; } { const v4f l = GDN_L4(50, 10); x50 -= l.x * x40; x50 -= l.y * x41; x50 -= l.z * x42; x50 -= l.w * x43; } { const v4f l = GDN_L4(50, 11); x50 -= l.x * x44; x50 -= l.y * x45; x50 -= l.z * x46; x50 -= l.w * x47; } { const v4f l = GDN_L4(50, 12); x50 -= l.x * x48; x50 -= l.y * x49; } __builtin_amdgcn_sched_barrier(0);
        float x51 = GDN_RHS(51); { const v4f l = GDN_L4(51, 0); x51 -= l.x * x0; x51 -= l.y * x1; x51 -= l.z * x2; x51 -= l.w * x3; } { const v4f l = GDN_L4(51, 1); x51 -= l.x * x4; x51 -= l.y * x5; x51 -= l.z * x6; x51 -= l.w * x7; } { const v4f l = GDN_L4(51, 2); x51 -= l.x * x8; x51 -= l.y * x9; x51 -= l.z * x10; x51 -= l.w * x11; } { const v4f l = GDN_L4(51, 3); x51 -= l.x * x12; x51 -= l.y * x13; x51 -= l.z * x14; x51 -= l.w * x15; } { const v4f l = GDN_L4(51, 4); x51 -= l.x * x16; x51 -= l.y * x17; x51 -= l.z * x18; x51 -= l.w * x19; } { const v4f l = GDN_L4(51, 5); x51 -= l.x * x20; x51 -= l.y * x21; x51 -= l.z * x22; x51 -= l.w * x23; } { const v4f l = GDN_L4(51, 6); x51 -= l.x * x24; x51 -= l.y * x25; x51 -= l.z * x26; x51 -= l.w * x27; } { const v4f l = GDN_L4(51, 7); x51 -= l.x * x28; x51 -= l.y * x29; x51 -= l.z * x30; x51 -= l.w * x31; } { const v4f l = GDN_L4(51, 8); x51 -= l.x * x32; x51 -= l.y * x33; x51 -= l.z * x34; x51 -= l.w * x35; } { const v4f l = GDN_L4(51, 9); x51 -= l.x * x36; x51 -= l.y * x37; x51 -= l.z * x38; x51 -= l.w * x39; } { const v4f l = GDN_L4(51, 10); x51 -= l.x * x40; x51 -= l.y * x41; x51 -= l.z * x42; x51 -= l.w * x43; } { const v4f l = GDN_L4(51, 11); x51 -= l.x * x44; x51 -= l.y * x45; x51 -= l.z * x46; x51 -= l.w * x47; } { const v4f l = GDN_L4(51, 12); x51 -= l.x * x48; x51 -= l.y * x49; x51 -= l.z * x50; } __builtin_amdgcn_sched_barrier(0);
        float x52 = GDN_RHS(52); { const v4f l = GDN_L4(52, 0); x52 -= l.x * x0; x52 -= l.y * x1; x52 -= l.z * x2; x52 -= l.w * x3; } { const v4f l = GDN_L4(52, 1); x52 -= l.x * x4; x52 -= l.y * x5; x52 -= l.z * x6; x52 -= l.w * x7; } { const v4f l = GDN_L4(52, 2); x52 -= l.x * x8; x52 -= l.y * x9; x52 -= l.z * x10; x52 -= l.w * x11; } { const v4f l = GDN_L4(52, 3); x52 -= l.x * x12; x52 -= l.y * x13; x52 -= l.z * x14; x52 -= l.w * x15; } { const v4f l = GDN_L4(52, 4); x52 -= l.x * x16; x52 -= l.y * x17; x52 -= l.z * x18; x52 -= l.w * x19; } { const v4f l = GDN_L4(52, 5); x52 -= l.x * x20; x52 -= l.y * x21; x52 -= l.z * x22; x52 -= l.w * x23; } { const v4f l = GDN_L4(52, 6); x52 -= l.x * x24; x52 -= l.y * x25; x52 -= l.z * x26; x52 -= l.w * x27; } { const v4f l = GDN_L4(52, 7); x52 -= l.x * x28; x52 -= l.y * x29; x52 -= l.z * x30; x52 -= l.w * x31; } { const v4f l = GDN_L4(52, 8); x52 -= l.x * x32; x52 -= l.y * x33; x52 -= l.z * x34; x52 -= l.w * x35; } { const v4f l = GDN_L4(52, 9); x52 -= l.x * x36; x52 -= l.y * x37; x52 -= l.z * x38; x52 -= l.w * x39; } { const v4f l = GDN_L4(52, 10); x52 -= l.x * x40; x52 -= l.y * x41; x52 -= l.z * x42; x52 -= l.w * x43; } { const v4f l = GDN_L4(52, 11); x52 -= l.x * x44; x52 -= l.y * x45; x52 -= l.z * x46; x52 -= l.w * x47; } { const v4f l = GDN_L4(52, 12); x52 -= l.x * x48; x52 -= l.y * x49; x52 -= l.z * x50; x52 -= l.w * x51; } __builtin_amdgcn_sched_barrier(0);
        float x53 = GDN_RHS(53); { const v4f l = GDN_L4(53, 0); x53 -= l.x * x0; x53 -= l.y * x1; x53 -= l.z * x2; x53 -= l.w * x3; } { const v4f l = GDN_L4(53, 1); x53 -= l.x * x4; x53 -= l.y * x5; x53 -= l.z * x6; x53 -= l.w * x7; } { const v4f l = GDN_L4(53, 2); x53 -= l.x * x8; x53 -= l.y * x9; x53 -= l.z * x10; x53 -= l.w * x11; } { const v4f l = GDN_L4(53, 3); x53 -= l.x * x12; x53 -= l.y * x13; x53 -= l.z * x14; x53 -= l.w * x15; } { const v4f l = GDN_L4(53, 4); x53 -= l.x * x16; x53 -= l.y * x17; x53 -= l.z * x18; x53 -= l.w * x19; } { const v4f l = GDN_L4(53, 5); x53 -= l.x * x20; x53 -= l.y * x21; x53 -= l.z * x22; x53 -= l.w * x23; } { const v4f l = GDN_L4(53, 6); x53 -= l.x * x24; x53 -= l.y * x25; x53 -= l.z * x26; x53 -= l.w * x27; } { const v4f l = GDN_L4(53, 7); x53 -= l.x * x28; x53 -= l.y * x29; x53 -= l.z * x30; x53 -= l.w * x31; } { const v4f l = GDN_L4(53, 8); x53 -= l.x * x32; x53 -= l.y * x33; x53 -= l.z * x34; x53 -= l.w * x35; } { const v4f l = GDN_L4(53, 9); x53 -= l.x * x36; x53 -= l.y * x37; x53 -= l.z * x38; x53 -= l.w * x39; } { const v4f l = GDN_L4(53, 10); x53 -= l.x * x40; x53 -= l.y * x41; x53 -= l.z * x42; x53 -= l.w * x43; } { const v4f l = GDN_L4(53, 11); x53 -= l.x * x44; x53 -= l.y * x45; x53 -= l.z * x46; x53 -= l.w * x47; } { const v4f l = GDN_L4(53, 12); x53 -= l.x * x48; x53 -= l.y * x49; x53 -= l.z * x50; x53 -= l.w * x51; } { const v4f l = GDN_L4(53, 13); x53 -= l.x * x52; } __builtin_amdgcn_sched_barrier(0);
        float x54 = GDN_RHS(54); { const v4f l = GDN_L4(54, 0); x54 -= l.x * x0; x54 -= l.y * x1; x54 -= l.z * x2; x54 -= l.w * x3; } { const v4f l = GDN_L4(54, 1); x54 -= l.x * x4; x54 -= l.y * x5; x54 -= l.z * x6; x54 -= l.w * x7; } { const v4f l = GDN_L4(54, 2); x54 -= l.x * x8; x54 -= l.y * x9; x54 -= l.z * x10; x54 -= l.w * x11; } { const v4f l = GDN_L4(54, 3); x54 -= l.x * x12; x54 -= l.y * x13; x54 -= l.z * x14; x54 -= l.w * x15; } { const v4f l = GDN_L4(54, 4); x54 -= l.x * x16; x54 -= l.y * x17; x54 -= l.z * x18; x54 -= l.w * x19; } { const v4f l = GDN_L4(54, 5); x54 -= l.x * x20; x54 -= l.y * x21; x54 -= l.z * x22; x54 -= l.w * x23; } { const v4f l = GDN_L4(54, 6); x54 -= l.x * x24; x54 -= l.y * x25; x54 -= l.z * x26; x54 -= l.w * x27; } { const v4f l = GDN_L4(54, 7); x54 -= l.x * x28; x54 -= l.y * x29; x54 -= l.z * x30; x54 -= l.w * x31; } { const v4f l = GDN_L4(54, 8); x54 -= l.x * x32; x54 -= l.y * x33; x54 -= l.z * x34; x54 -= l.w * x35; } { const v4f l = GDN_L4(54, 9); x54 -= l.x * x36; x54 -= l.y * x37; x54 -= l.z * x38; x54 -= l.w * x39; } { const v4f l = GDN_L4(54, 10); x54 -= l.x * x40; x54 -= l.y * x41; x54 -= l.z * x42; x54 -= l.w * x43; } { const v4f l = GDN_L4(54, 11); x54 -= l.x * x44; x54 -= l.y * x45; x54 -= l.z * x46; x54 -= l.w * x47; } { const v4f l = GDN_L4(54, 12); x54 -= l.x * x48; x54 -= l.y * x49; x54 -= l.z * x50; x54 -= l.w * x51; } { const v4f l = GDN_L4(54, 13); x54 -= l.x * x52; x54 -= l.y * x53; } __builtin_amdgcn_sched_barrier(0);
        float x55 = GDN_RHS(55); { const v4f l = GDN_L4(55, 0); x55 -= l.x * x0; x55 -= l.y * x1; x55 -= l.z * x2; x55 -= l.w * x3; } { const v4f l = GDN_L4(55, 1); x55 -= l.x * x4; x55 -= l.y * x5; x55 -= l.z * x6; x55 -= l.w * x7; } { const v4f l = GDN_L4(55, 2); x55 -= l.x * x8; x55 -= l.y * x9; x55 -= l.z * x10; x55 -= l.w * x11; } { const v4f l = GDN_L4(55, 3); x55 -= l.x * x12; x55 -= l.y * x13; x55 -= l.z * x14; x55 -= l.w * x15; } { const v4f l = GDN_L4(55, 4); x55 -= l.x * x16; x55 -= l.y * x17; x55 -= l.z * x18; x55 -= l.w * x19; } { const v4f l = GDN_L4(55, 5); x55 -= l.x * x20; x55 -= l.y * x21; x55 -= l.z * x22; x55 -= l.w * x23; } { const v4f l = GDN_L4(55, 6); x55 -= l.x * x24; x55 -= l.y * x25; x55 -= l.z * x26; x55 -= l.w * x27; } { const v4f l = GDN_L4(55, 7); x55 -= l.x * x28; x55 -= l.y * x29; x55 -= l.z * x30; x55 -= l.w * x31; } { const v4f l = GDN_L4(55, 8); x55 -= l.x * x32; x55 -= l.y * x33; x55 -= l.z * x34; x55 -= l.w * x35; } { const v4f l = GDN_L4(55, 9); x55 -= l.x * x36; x55 -= l.y * x37; x55 -= l.z * x38; x55 -= l.w * x39; } { const v4f l = GDN_L4(55, 10); x55 -= l.x * x40; x55 -= l.y * x41; x55 -= l.z * x42; x55 -= l.w * x43; } { const v4f l = GDN_L4(55, 11); x55 -= l.x * x44; x55 -= l.y * x45; x55 -= l.z * x46; x55 -= l.w * x47; } { const v4f l = GDN_L4(55, 12); x55 -= l.x * x48; x55 -= l.y * x49; x55 -= l.z * x50; x55 -= l.w * x51; } { const v4f l = GDN_L4(55, 13); x55 -= l.x * x52; x55 -= l.y * x53; x55 -= l.z * x54; } __builtin_amdgcn_sched_barrier(0);
        float x56 = GDN_RHS(56); { const v4f l = GDN_L4(56, 0); x56 -= l.x * x0; x56 -= l.y * x1; x56 -= l.z * x2; x56 -= l.w * x3; } { const v4f l = GDN_L4(56, 1); x56 -= l.x * x4; x56 -= l.y * x5; x56 -= l.z * x6; x56 -= l.w * x7; } { const v4f l = GDN_L4(56, 2); x56 -= l.x * x8; x56 -= l.y * x9; x56 -= l.z * x10; x56 -= l.w * x11; } { const v4f l = GDN_L4(56, 3); x56 -= l.x * x12; x56 -= l.y * x13; x56 -= l.z * x14; x56 -= l.w * x15; } { const v4f l = GDN_L4(56, 4); x56 -= l.x * x16; x56 -= l.y * x17; x56 -= l.z * x18; x56 -= l.w * x19; } { const v4f l = GDN_L4(56, 5); x56 -= l.x * x20; x56 -= l.y * x21; x56 -= l.z * x22; x56 -= l.w * x23; } { const v4f l = GDN_L4(56, 6); x56 -= l.x * x24; x56 -= l.y * x25; x56 -= l.z * x26; x56 -= l.w * x27; } { const v4f l = GDN_L4(56, 7); x56 -= l.x * x28; x56 -= l.y * x29; x56 -= l.z * x30; x56 -= l.w * x31; } { const v4f l = GDN_L4(56, 8); x56 -= l.x * x32; x56 -= l.y * x33; x56 -= l.z * x34; x56 -= l.w * x35; } { const v4f l = GDN_L4(56, 9); x56 -= l.x * x36; x56 -= l.y * x37; x56 -= l.z * x38; x56 -= l.w * x39; } { const v4f l = GDN_L4(56, 10); x56 -= l.x * x40; x56 -= l.y * x41; x56 -= l.z * x42; x56 -= l.w * x43; } { const v4f l = GDN_L4(56, 11); x56 -= l.x * x44; x56 -= l.y * x45; x56 -= l.z * x46; x56 -= l.w * x47; } { const v4f l = GDN_L4(56, 12); x56 -= l.x * x48; x56 -= l.y * x49; x56 -= l.z * x50; x56 -= l.w * x51; } { const v4f l = GDN_L4(56, 13); x56 -= l.x * x52; x56 -= l.y * x53; x56 -= l.z * x54; x56 -= l.w * x55; } __builtin_amdgcn_sched_barrier(0);
        float x57 = GDN_RHS(57); { const v4f l = GDN_L4(57, 0); x57 -= l.x * x0; x57 -= l.y * x1; x57 -= l.z * x2; x57 -= l.w * x3; } { const v4f l = GDN_L4(57, 1); x57 -= l.x * x4; x57 -= l.y * x5; x57 -= l.z * x6; x57 -= l.w * x7; } { const v4f l = GDN_L4(57, 2); x57 -= l.x * x8; x57 -= l.y * x9; x57 -= l.z * x10; x57 -= l.w * x11; } { const v4f l = GDN_L4(57, 3); x57 -= l.x * x12; x57 -= l.y * x13; x57 -= l.z * x14; x57 -= l.w * x15; } { const v4f l = GDN_L4(57, 4); x57 -= l.x * x16; x57 -= l.y * x17; x57 -= l.z * x18; x57 -= l.w * x19; } { const v4f l = GDN_L4(57, 5); x57 -= l.x * x20; x57 -= l.y * x21; x57 -= l.z * x22; x57 -= l.w * x23; } { const v4f l = GDN_L4(57, 6); x57 -= l.x * x24; x57 -= l.y * x25; x57 -= l.z * x26; x57 -= l.w * x27; } { const v4f l = GDN_L4(57, 7); x57 -= l.x * x28; x57 -= l.y * x29; x57 -= l.z * x30; x57 -= l.w * x31; } { const v4f l = GDN_L4(57, 8); x57 -= l.x * x32; x57 -= l.y * x33; x57 -= l.z * x34; x57 -= l.w * x35; } { const v4f l = GDN_L4(57, 9); x57 -= l.x * x36; x57 -= l.y * x37; x57 -= l.z * x38; x57 -= l.w * x39; } { const v4f l = GDN_L4(57, 10); x57 -= l.x * x40; x57 -= l.y * x41; x57 -= l.z * x42; x57 -= l.w * x43; } { const v4f l = GDN_L4(57, 11); x57 -= l.x * x44; x57 -= l.y * x45; x57 -= l.z * x46; x57 -= l.w * x47; } { const v4f l = GDN_L4(57, 12); x57 -= l.x * x48; x57 -= l.y * x49; x57 -= l.z * x50; x57 -= l.w * x51; } { const v4f l = GDN_L4(57, 13); x57 -= l.x * x52; x57 -= l.y * x53; x57 -= l.z * x54; x57 -= l.w * x55; } { const v4f l = GDN_L4(57, 14); x57 -= l.x * x56; } __builtin_amdgcn_sched_barrier(0);
        float x58 = GDN_RHS(58); { const v4f l = GDN_L4(58, 0); x58 -= l.x * x0; x58 -= l.y * x1; x58 -= l.z * x2; x58 -= l.w * x3; } { const v4f l = GDN_L4(58, 1); x58 -= l.x * x4; x58 -= l.y * x5; x58 -= l.z * x6; x58 -= l.w * x7; } { const v4f l = GDN_L4(58, 2); x58 -= l.x * x8; x58 -= l.y * x9; x58 -= l.z * x10; x58 -= l.w * x11; } { const v4f l = GDN_L4(58, 3); x58 -= l.x * x12; x58 -= l.y * x13; x58 -= l.z * x14; x58 -= l.w * x15; } { const v4f l = GDN_L4(58, 4); x58 -= l.x * x16; x58 -= l.y * x17; x58 -= l.z * x18; x58 -= l.w * x19; } { const v4f l = GDN_L4(58, 5); x58 -= l.x * x20; x58 -= l.y * x21; x58 -= l.z * x22; x58 -= l.w * x23; } { const v4f l = GDN_L4(58, 6); x58 -= l.x * x24; x58 -= l.y * x25; x58 -= l.z * x26; x58 -= l.w * x27; } { const v4f l = GDN_L4(58, 7); x58 -= l.x * x28; x58 -= l.y * x29; x58 -= l.z * x30; x58 -= l.w * x31; } { const v4f l = GDN_L4(58, 8); x58 -= l.x * x32; x58 -= l.y * x33; x58 -= l.z * x34; x58 -= l.w * x35; } { const v4f l = GDN_L4(58, 9); x58 -= l.x * x36; x58 -= l.y * x37; x58 -= l.z * x38; x58 -= l.w * x39; } { const v4f l = GDN_L4(58, 10); x58 -= l.x * x40; x58 -= l.y * x41; x58 -= l.z * x42; x58 -= l.w * x43; } { const v4f l = GDN_L4(58, 11); x58 -= l.x * x44; x58 -= l.y * x45; x58 -= l.z * x46; x58 -= l.w * x47; } { const v4f l = GDN_L4(58, 12); x58 -= l.x * x48; x58 -= l.y * x49; x58 -= l.z * x50; x58 -= l.w * x51; } { const v4f l = GDN_L4(58, 13); x58 -= l.x * x52; x58 -= l.y * x53; x58 -= l.z * x54; x58 -= l.w * x55; } { const v4f l = GDN_L4(58, 14); x58 -= l.x * x56; x58 -= l.y * x57; } __builtin_amdgcn_sched_barrier(0);
        float x59 = GDN_RHS(59); { const v4f l = GDN_L4(59, 0); x59 -= l.x * x0; x59 -= l.y * x1; x59 -= l.z * x2; x59 -= l.w * x3; } { const v4f l = GDN_L4(59, 1); x59 -= l.x * x4; x59 -= l.y * x5; x59 -= l.z * x6; x59 -= l.w * x7; } { const v4f l = GDN_L4(59, 2); x59 -= l.x * x8; x59 -= l.y * x9; x59 -= l.z * x10; x59 -= l.w * x11; } { const v4f l = GDN_L4(59, 3); x59 -= l.x * x12; x59 -= l.y * x13; x59 -= l.z * x14; x59 -= l.w * x15; } { const v4f l = GDN_L4(59, 4); x59 -= l.x * x16; x59 -= l.y * x17; x59 -= l.z * x18; x59 -= l.w * x19; } { const v4f l = GDN_L4(59, 5); x59 -= l.x * x20; x59 -= l.y * x21; x59 -= l.z * x22; x59 -= l.w * x23; } { const v4f l = GDN_L4(59, 6); x59 -= l.x * x24; x59 -= l.y * x25; x59 -= l.z * x26; x59 -= l.w * x27; } { const v4f l = GDN_L4(59, 7); x59 -= l.x * x28; x59 -= l.y * x29; x59 -= l.z * x30; x59 -= l.w * x31; } { const v4f l = GDN_L4(59, 8); x59 -= l.x * x32; x59 -= l.y * x33; x59 -= l.z * x34; x59 -= l.w * x35; } { const v4f l = GDN_L4(59, 9); x59 -= l.x * x36; x59 -= l.y * x37; x59 -= l.z * x38; x59 -= l.w * x39; } { const v4f l = GDN_L4(59, 10); x59 -= l.x * x40; x59 -= l.y * x41; x59 -= l.z * x42; x59 -= l.w * x43; } { const v4f l = GDN_L4(59, 11); x59 -= l.x * x44; x59 -= l.y * x45; x59 -= l.z * x46; x59 -= l.w * x47; } { const v4f l = GDN_L4(59, 12); x59 -= l.x * x48; x59 -= l.y * x49; x59 -= l.z * x50; x59 -= l.w * x51; } { const v4f l = GDN_L4(59, 13); x59 -= l.x * x52; x59 -= l.y * x53; x59 -= l.z * x54; x59 -= l.w * x55; } { const v4f l = GDN_L4(59, 14); x59 -= l.x * x56; x59 -= l.y * x57; x59 -= l.z * x58; } __builtin_amdgcn_sched_barrier(0);
        float x60 = GDN_RHS(60); { const v4f l = GDN_L4(60, 0); x60 -= l.x * x0; x60 -= l.y * x1; x60 -= l.z * x2; x60 -= l.w * x3; } { const v4f l = GDN_L4(60, 1); x60 -= l.x * x4; x60 -= l.y * x5; x60 -= l.z * x6; x60 -= l.w * x7; } { const v4f l = GDN_L4(60, 2); x60 -= l.x * x8; x60 -= l.y * x9; x60 -= l.z * x10; x60 -= l.w * x11; } { const v4f l = GDN_L4(60, 3); x60 -= l.x * x12; x60 -= l.y * x13; x60 -= l.z * x14; x60 -= l.w * x15; } { const v4f l = GDN_L4(60, 4); x60 -= l.x * x16; x60 -= l.y * x17; x60 -= l.z * x18; x60 -= l.w * x19; } { const v4f l = GDN_L4(60, 5); x60 -= l.x * x20; x60 -= l.y * x21; x60 -= l.z * x22; x60 -= l.w * x23; } { const v4f l = GDN_L4(60, 6); x60 -= l.x * x24; x60 -= l.y * x25; x60 -= l.z * x26; x60 -= l.w * x27; } { const v4f l = GDN_L4(60, 7); x60 -= l.x * x28; x60 -= l.y * x29; x60 -= l.z * x30; x60 -= l.w * x31; } { const v4f l = GDN_L4(60, 8); x60 -= l.x * x32; x60 -= l.y * x33; x60 -= l.z * x34; x60 -= l.w * x35; } { const v4f l = GDN_L4(60, 9); x60 -= l.x * x36; x60 -= l.y * x37; x60 -= l.z * x38; x60 -= l.w * x39; } { const v4f l = GDN_L4(60, 10); x60 -= l.x * x40; x60 -= l.y * x41; x60 -= l.z * x42; x60 -= l.w * x43; } { const v4f l = GDN_L4(60, 11); x60 -= l.x * x44; x60 -= l.y * x45; x60 -= l.z * x46; x60 -= l.w * x47; } { const v4f l = GDN_L4(60, 12); x60 -= l.x * x48; x60 -= l.y * x49; x60 -= l.z * x50; x60 -= l.w * x51; } { const v4f l = GDN_L4(60, 13); x60 -= l.x * x52; x60 -= l.y * x53; x60 -= l.z * x54; x60 -= l.w * x55; } { const v4f l = GDN_L4(60, 14); x60 -= l.x * x56; x60 -= l.y * x57; x60 -= l.z * x58; x60 -= l.w * x59; } __builtin_amdgcn_sched_barrier(0);
        float x61 = GDN_RHS(61); { const v4f l = GDN_L4(61, 0); x61 -= l.x * x0; x61 -= l.y * x1; x61 -= l.z * x2; x61 -= l.w * x3; } { const v4f l = GDN_L4(61, 1); x61 -= l.x * x4; x61 -= l.y * x5; x61 -= l.z * x6; x61 -= l.w * x7; } { const v4f l = GDN_L4(61, 2); x61 -= l.x * x8; x61 -= l.y * x9; x61 -= l.z * x10; x61 -= l.w * x11; } { const v4f l = GDN_L4(61, 3); x61 -= l.x * x12; x61 -= l.y * x13; x61 -= l.z * x14; x61 -= l.w * x15; } { const v4f l = GDN_L4(61, 4); x61 -= l.x * x16; x61 -= l.y * x17; x61 -= l.z * x18; x61 -= l.w * x19; } { const v4f l = GDN_L4(61, 5); x61 -= l.x * x20; x61 -= l.y * x21; x61 -= l.z * x22; x61 -= l.w * x23; } { const v4f l = GDN_L4(61, 6); x61 -= l.x * x24; x61 -= l.y * x25; x61 -= l.z * x26; x61 -= l.w * x27; } { const v4f l = GDN_L4(61, 7); x61 -= l.x * x28; x61 -= l.y * x29; x61 -= l.z * x30; x61 -= l.w * x31; } { const v4f l = GDN_L4(61, 8); x61 -= l.x * x32; x61 -= l.y * x33; x61 -= l.z * x34; x61 -= l.w * x35; } { const v4f l = GDN_L4(61, 9); x61 -= l.x * x36; x61 -= l.y * x37; x61 -= l.z * x38; x61 -= l.w * x39; } { const v4f l = GDN_L4(61, 10); x61 -= l.x * x40; x61 -= l.y * x41; x61 -= l.z * x42; x61 -= l.w * x43; } { const v4f l = GDN_L4(61, 11); x61 -= l.x * x44; x61 -= l.y * x45; x61 -= l.z * x46; x61 -= l.w * x47; } { const v4f l = GDN_L4(61, 12); x61 -= l.x * x48; x61 -= l.y * x49; x61 -= l.z * x50; x61 -= l.w * x51; } { const v4f l = GDN_L4(61, 13); x61 -= l.x * x52; x61 -= l.y * x53; x61 -= l.z * x54; x61 -= l.w * x55; } { const v4f l = GDN_L4(61, 14); x61 -= l.x * x56; x61 -= l.y * x57; x61 -= l.z * x58; x61 -= l.w * x59; } { const v4f l = GDN_L4(61, 15); x61 -= l.x * x60; } __builtin_amdgcn_sched_barrier(0);
        float x62 = GDN_RHS(62); { const v4f l = GDN_L4(62, 0); x62 -= l.x * x0; x62 -= l.y * x1; x62 -= l.z * x2; x62 -= l.w * x3; } { const v4f l = GDN_L4(62, 1); x62 -= l.x * x4; x62 -= l.y * x5; x62 -= l.z * x6; x62 -= l.w * x7; } { const v4f l = GDN_L4(62, 2); x62 -= l.x * x8; x62 -= l.y * x9; x62 -= l.z * x10; x62 -= l.w * x11; } { const v4f l = GDN_L4(62, 3); x62 -= l.x * x12; x62 -= l.y * x13; x62 -= l.z * x14; x62 -= l.w * x15; } { const v4f l = GDN_L4(62, 4); x62 -= l.x * x16; x62 -= l.y * x17; x62 -= l.z * x18; x62 -= l.w * x19; } { const v4f l = GDN_L4(62, 5); x62 -= l.x * x20; x62 -= l.y * x21; x62 -= l.z * x22; x62 -= l.w * x23; } { const v4f l = GDN_L4(62, 6); x62 -= l.x * x24; x62 -= l.y * x25; x62 -= l.z * x26; x62 -= l.w * x27; } { const v4f l = GDN_L4(62, 7); x62 -= l.x * x28; x62 -= l.y * x29; x62 -= l.z * x30; x62 -= l.w * x31; } { const v4f l = GDN_L4(62, 8); x62 -= l.x * x32; x62 -= l.y * x33; x62 -= l.z * x34; x62 -= l.w * x35; } { const v4f l = GDN_L4(62, 9); x62 -= l.x * x36; x62 -= l.y * x37; x62 -= l.z * x38; x62 -= l.w * x39; } { const v4f l = GDN_L4(62, 10); x62 -= l.x * x40; x62 -= l.y * x41; x62 -= l.z * x42; x62 -= l.w * x43; } { const v4f l = GDN_L4(62, 11); x62 -= l.x * x44; x62 -= l.y * x45; x62 -= l.z * x46; x62 -= l.w * x47; } { const v4f l = GDN_L4(62, 12); x62 -= l.x * x48; x62 -= l.y * x49; x62 -= l.z * x50; x62 -= l.w * x51; } { const v4f l = GDN_L4(62, 13); x62 -= l.x * x52; x62 -= l.y * x53; x62 -= l.z * x54; x62 -= l.w * x55; } { const v4f l = GDN_L4(62, 14); x62 -= l.x * x56; x62 -= l.y * x57; x62 -= l.z * x58; x62 -= l.w * x59; } { const v4f l = GDN_L4(62, 15); x62 -= l.x * x60; x62 -= l.y * x61; } __builtin_amdgcn_sched_barrier(0);
        float x63 = GDN_RHS(63); { const v4f l = GDN_L4(63, 0); x63 -= l.x * x0; x63 -= l.y * x1; x63 -= l.z * x2; x63 -= l.w * x3; } { const v4f l = GDN_L4(63, 1); x63 -= l.x * x4; x63 -= l.y * x5; x63 -= l.z * x6; x63 -= l.w * x7; } { const v4f l = GDN_L4(63, 2); x63 -= l.x * x8; x63 -= l.y * x9; x63 -= l.z * x10; x63 -= l.w * x11; } { const v4f l = GDN_L4(63, 3); x63 -= l.x * x12; x63 -= l.y * x13; x63 -= l.z * x14; x63 -= l.w * x15; } { const v4f l = GDN_L4(63, 4); x63 -= l.x * x16; x63 -= l.y * x17; x63 -= l.z * x18; x63 -= l.w * x19; } { const v4f l = GDN_L4(63, 5); x63 -= l.x * x20; x63 -= l.y * x21; x63 -= l.z * x22; x63 -= l.w * x23; } { const v4f l = GDN_L4(63, 6); x63 -= l.x * x24; x63 -= l.y * x25; x63 -= l.z * x26; x63 -= l.w * x27; } { const v4f l = GDN_L4(63, 7); x63 -= l.x * x28; x63 -= l.y * x29; x63 -= l.z * x30; x63 -= l.w * x31; } { const v4f l = GDN_L4(63, 8); x63 -= l.x * x32; x63 -= l.y * x33; x63 -= l.z * x34; x63 -= l.w * x35; } { const v4f l = GDN_L4(63, 9); x63 -= l.x * x36; x63 -= l.y * x37; x63 -= l.z * x38; x63 -= l.w * x39; } { const v4f l = GDN_L4(63, 10); x63 -= l.x * x40; x63 -= l.y * x41; x63 -= l.z * x42; x63 -= l.w * x43; } { const v4f l = GDN_L4(63, 11); x63 -= l.x * x44; x63 -= l.y * x45; x63 -= l.z * x46; x63 -= l.w * x47; } { const v4f l = GDN_L4(63, 12); x63 -= l.x * x48; x63 -= l.y * x49; x63 -= l.z * x50; x63 -= l.w * x51; } { const v4f l = GDN_L4(63, 13); x63 -= l.x * x52; x63 -= l.y * x53; x63 -= l.z * x54; x63 -= l.w * x55; } { const v4f l = GDN_L4(63, 14); x63 -= l.x * x56; x63 -= l.y * x57; x63 -= l.z * x58; x63 -= l.w * x59; } { const v4f l = GDN_L4(63, 15); x63 -= l.x * x60; x63 -= l.y * x61; x63 -= l.z * x62; } __builtin_amdgcn_sched_barrier(0);
        if (c < 128) { GU[0 * 128 + c] = x0; GU[1 * 128 + c] = x1; GU[2 * 128 + c] = x2; GU[3 * 128 + c] = x3; GU[4 * 128 + c] = x4; GU[5 * 128 + c] = x5; GU[6 * 128 + c] = x6; GU[7 * 128 + c] = x7; GU[8 * 128 + c] = x8; GU[9 * 128 + c] = x9; GU[10 * 128 + c] = x10; GU[11 * 128 + c] = x11; GU[12 * 128 + c] = x12; GU[13 * 128 + c] = x13; GU[14 * 128 + c] = x14; GU[15 * 128 + c] = x15; GU[16 * 128 + c] = x16; GU[17 * 128 + c] = x17; GU[18 * 128 + c] = x18; GU[19 * 128 + c] = x19; GU[20 * 128 + c] = x20; GU[21 * 128 + c] = x21; GU[22 * 128 + c] = x22; GU[23 * 128 + c] = x23; GU[24 * 128 + c] = x24; GU[25 * 128 + c] = x25; GU[26 * 128 + c] = x26; GU[27 * 128 + c] = x27; GU[28 * 128 + c] = x28; GU[29 * 128 + c] = x29; GU[30 * 128 + c] = x30; GU[31 * 128 + c] = x31; GU[32 * 128 + c] = x32; GU[33 * 128 + c] = x33; GU[34 * 128 + c] = x34; GU[35 * 128 + c] = x35; GU[36 * 128 + c] = x36; GU[37 * 128 + c] = x37; GU[38 * 128 + c] = x38; GU[39 * 128 + c] = x39; GU[40 * 128 + c] = x40; GU[41 * 128 + c] = x41; GU[42 * 128 + c] = x42; GU[43 * 128 + c] = x43; GU[44 * 128 + c] = x44; GU[45 * 128 + c] = x45; GU[46 * 128 + c] = x46; GU[47 * 128 + c] = x47; GU[48 * 128 + c] = x48; GU[49 * 128 + c] = x49; GU[50 * 128 + c] = x50; GU[51 * 128 + c] = x51; GU[52 * 128 + c] = x52; GU[53 * 128 + c] = x53; GU[54 * 128 + c] = x54; GU[55 * 128 + c] = x55; GU[56 * 128 + c] = x56; GU[57 * 128 + c] = x57; GU[58 * 128 + c] = x58; GU[59 * 128 + c] = x59; GU[60 * 128 + c] = x60; GU[61 * 128 + c] = x61; GU[62 * 128 + c] = x62; GU[63 * 128 + c] = x63; }
        else { GNW[0 * 128 + (c - 128)] = (bf16)f2bf(-x0); GNW[1 * 128 + (c - 128)] = (bf16)f2bf(-x1); GNW[2 * 128 + (c - 128)] = (bf16)f2bf(-x2); GNW[3 * 128 + (c - 128)] = (bf16)f2bf(-x3); GNW[4 * 128 + (c - 128)] = (bf16)f2bf(-x4); GNW[5 * 128 + (c - 128)] = (bf16)f2bf(-x5); GNW[6 * 128 + (c - 128)] = (bf16)f2bf(-x6); GNW[7 * 128 + (c - 128)] = (bf16)f2bf(-x7); GNW[8 * 128 + (c - 128)] = (bf16)f2bf(-x8); GNW[9 * 128 + (c - 128)] = (bf16)f2bf(-x9); GNW[10 * 128 + (c - 128)] = (bf16)f2bf(-x10); GNW[11 * 128 + (c - 128)] = (bf16)f2bf(-x11); GNW[12 * 128 + (c - 128)] = (bf16)f2bf(-x12); GNW[13 * 128 + (c - 128)] = (bf16)f2bf(-x13); GNW[14 * 128 + (c - 128)] = (bf16)f2bf(-x14); GNW[15 * 128 + (c - 128)] = (bf16)f2bf(-x15); GNW[16 * 128 + (c - 128)] = (bf16)f2bf(-x16); GNW[17 * 128 + (c - 128)] = (bf16)f2bf(-x17); GNW[18 * 128 + (c - 128)] = (bf16)f2bf(-x18); GNW[19 * 128 + (c - 128)] = (bf16)f2bf(-x19); GNW[20 * 128 + (c - 128)] = (bf16)f2bf(-x20); GNW[21 * 128 + (c - 128)] = (bf16)f2bf(-x21); GNW[22 * 128 + (c - 128)] = (bf16)f2bf(-x22); GNW[23 * 128 + (c - 128)] = (bf16)f2bf(-x23); GNW[24 * 128 + (c - 128)] = (bf16)f2bf(-x24); GNW[25 * 128 + (c - 128)] = (bf16)f2bf(-x25); GNW[26 * 128 + (c - 128)] = (bf16)f2bf(-x26); GNW[27 * 128 + (c - 128)] = (bf16)f2bf(-x27); GNW[28 * 128 + (c - 128)] = (bf16)f2bf(-x28); GNW[29 * 128 + (c - 128)] = (bf16)f2bf(-x29); GNW[30 * 128 + (c - 128)] = (bf16)f2bf(-x30); GNW[31 * 128 + (c - 128)] = (bf16)f2bf(-x31); GNW[32 * 128 + (c - 128)] = (bf16)f2bf(-x32); GNW[33 * 128 + (c - 128)] = (bf16)f2bf(-x33); GNW[34 * 128 + (c - 128)] = (bf16)f2bf(-x34); GNW[35 * 128 + (c - 128)] = (bf16)f2bf(-x35); GNW[36 * 128 + (c - 128)] = (bf16)f2bf(-x36); GNW[37 * 128 + (c - 128)] = (bf16)f2bf(-x37); GNW[38 * 128 + (c - 128)] = (bf16)f2bf(-x38); GNW[39 * 128 + (c - 128)] = (bf16)f2bf(-x39); GNW[40 * 128 + (c - 128)] = (bf16)f2bf(-x40); GNW[41 * 128 + (c - 128)] = (bf16)f2bf(-x41); GNW[42 * 128 + (c - 128)] = (bf16)f2bf(-x42); GNW[43 * 128 + (c - 128)] = (bf16)f2bf(-x43); GNW[44 * 128 + (c - 128)] = (bf16)f2bf(-x44); GNW[45 * 128 + (c - 128)] = (bf16)f2bf(-x45); GNW[46 * 128 + (c - 128)] = (bf16)f2bf(-x46); GNW[47 * 128 + (c - 128)] = (bf16)f2bf(-x47); GNW[48 * 128 + (c - 128)] = (bf16)f2bf(-x48); GNW[49 * 128 + (c - 128)] = (bf16)f2bf(-x49); GNW[50 * 128 + (c - 128)] = (bf16)f2bf(-x50); GNW[51 * 128 + (c - 128)] = (bf16)f2bf(-x51); GNW[52 * 128 + (c - 128)] = (bf16)f2bf(-x52); GNW[53 * 128 + (c - 128)] = (bf16)f2bf(-x53); GNW[54 * 128 + (c - 128)] = (bf16)f2bf(-x54); GNW[55 * 128 + (c - 128)] = (bf16)f2bf(-x55); GNW[56 * 128 + (c - 128)] = (bf16)f2bf(-x56); GNW[57 * 128 + (c - 128)] = (bf16)f2bf(-x57); GNW[58 * 128 + (c - 128)] = (bf16)f2bf(-x58); GNW[59 * 128 + (c - 128)] = (bf16)f2bf(-x59); GNW[60 * 128 + (c - 128)] = (bf16)f2bf(-x60); GNW[61 * 128 + (c - 128)] = (bf16)f2bf(-x61); GNW[62 * 128 + (c - 128)] = (bf16)f2bf(-x62); GNW[63 * 128 + (c - 128)] = (bf16)f2bf(-x63); }
#undef GDN_RHS
#undef GDN_L4
    } else {
        const int t2 = tid - 256; const float gl = gcs[63];
        { const int i = t2 >> 2, d0 = (t2 & 3) * 32; const float e = __expf(gcs[i]);
#pragma unroll
          for (int x8 = 0; x8 < 4; ++x8) { const v4f a = *(const LAS v4f*)(qs + i * QP + d0 + 8 * x8), b = *(const LAS v4f*)(qs + i * QP + d0 + 8 * x8 + 4);
              v4u w; w.x = pk2(a.x * e, a.y * e); w.y = pk2(a.z * e, a.w * e); w.z = pk2(b.x * e, b.y * e); w.w = pk2(b.z * e, b.w * e); *(v4u*)(GQG + i * 128 + d0 + 8 * x8) = w; } }
        { const int d = t2 >> 1, j0 = (t2 & 1) * 32;
#pragma unroll
          for (int x8 = 0; x8 < 4; ++x8) { float o[8];
#pragma unroll
              for (int x = 0; x < 8; ++x) { const int j = j0 + 8 * x8 + x; o[x] = ks[j * QP + d] * __expf(gl - gcs[j]); }
              v4u w; w.x = pk2(o[0], o[1]); w.y = pk2(o[2], o[3]); w.z = pk2(o[4], o[5]); w.w = pk2(o[6], o[7]); *(v4u*)(GKT + d * 64 + j0 + 8 * x8) = w; } }
        if (t2 == 0) GDL[item] = __expf(gl);
    }
    __syncthreads();
}
struct GdnFrags { bf16x8_t nw[4], qg[4], at[2], kt[2][2]; float u[4]; float dl; };
__device__ __forceinline__ void gdn_load(GdnFrags& F, const Params& p, int item, int off128, int off64, int offk, int offu) {
    const bf16* GNW = (const bf16*)(p.ws + WS_GNW) + (size_t)item * 8192; const bf16* GQG = (const bf16*)(p.ws + WS_GQG) + (size_t)item * 8192;
    const bf16* GAT = (const bf16*)(p.ws + WS_GAT) + (size_t)item * 4096; const bf16* GKT = (const bf16*)(p.ws + WS_GKT) + (size_t)item * 8192; const float* GU = (const float*)(p.ws + WS_GU) + (size_t)item * 8192;
#pragma unroll
    for (int ks = 0; ks < 4; ++ks) { F.nw[ks] = *(const bf16x8_t*)(GNW + off128 + 32 * ks); F.qg[ks] = *(const bf16x8_t*)(GQG + off128 + 32 * ks); }
#pragma unroll
    for (int ks = 0; ks < 2; ++ks) { F.at[ks] = *(const bf16x8_t*)(GAT + off64 + 32 * ks); F.kt[0][ks] = *(const bf16x8_t*)(GKT + offk + 32 * ks); F.kt[1][ks] = *(const bf16x8_t*)(GKT + offk + 1024 + 32 * ks); }
#pragma unroll
    for (int r = 0; r < 4; ++r) F.u[r] = GU[offu + r * 128];
    F.dl = ((const float*)(p.ws + WS_GDL))[item];
}
constexpr int STP = 136, VNP = 72;
__device__ __forceinline__ void gdn_seq(const Params& p, LAS unsigned char* lds, int wgi, int wave, int lane) {
    const int u = wgi * 2 + (wave >> 2), wi = wave & 3, h = u >> 3, sl = u & 7, g = lane >> 4, c = lane & 15;
    LAS unsigned short* ST = (LAS unsigned short*)(lds + (wave >> 2) * 12288);
    LAS unsigned short* VNT = ST + 2 * 16 * STP;
    float* GO = (float*)(p.ws + WS_GO);
    const int off128 = (16 * wi + c) * 128 + 8 * g, off64 = (16 * wi + c) * 64 + 8 * g, offk = (32 * wi + c) * 64 + 8 * g, offu = (16 * wi + 4 * g) * 128 + 16 * sl + c;
#pragma unroll
    for (int mt = 0; mt < 2; ++mt) *(LAS v2u*)(ST + c * STP + 16 * (2 * wi + mt) + 4 * g) = (v2u){0u, 0u};
    pg8::f32x4 Sacc[2] = {{0.f, 0.f, 0.f, 0.f}, {0.f, 0.f, 0.f, 0.f}};
    __syncthreads();
    GdnFrags F0, F1;
    gdn_load(F0, p, h, off128, off64, offk, offu);
#define GDN_STEP(F, n_) do { const int cur = (n_) & 1; bf16x8_t sf[4]; \
        _Pragma("unroll") for (int ks = 0; ks < 4; ++ks) sf[ks] = *(const LAS bf16x8_t*)(ST + cur * 16 * STP + c * STP + 32 * ks + 8 * g); \
        pg8::f32x4 vn = {F.u[0], F.u[1], F.u[2], F.u[3]}; \
        _Pragma("unroll") for (int ks = 0; ks < 4; ++ks) vn = __builtin_amdgcn_mfma_f32_16x16x32_bf16(F.nw[ks], sf[ks], vn, 0, 0, 0); \
        { v2u w; w.x = pk2(vn[0], vn[1]); w.y = pk2(vn[2], vn[3]); *(LAS v2u*)(VNT + c * VNP + 16 * wi + 4 * g) = w; } \
        LDS_BAR(); \
        const bf16x8_t v0 = *(const LAS bf16x8_t*)(VNT + c * VNP + 8 * g), v1 = *(const LAS bf16x8_t*)(VNT + c * VNP + 32 + 8 * g); \
        pg8::f32x4 o = {0.f, 0.f, 0.f, 0.f}; \
        _Pragma("unroll") for (int ks = 0; ks < 4; ++ks) o = __builtin_amdgcn_mfma_f32_16x16x32_bf16(F.qg[ks], sf[ks], o, 0, 0, 0); \
        o = __builtin_amdgcn_mfma_f32_16x16x32_bf16(F.at[0], v0, o, 0, 0, 0); o = __builtin_amdgcn_mfma_f32_16x16x32_bf16(F.at[1], v1, o, 0, 0, 0); \
        { const size_t tb = (size_t)(n_) * 64 + 16 * wi + 4 * g; _Pragma("unroll") for (int r = 0; r < 4; ++r) GO[(tb + r) * BW + h * 128 + 16 * sl + c] = o[r]; } \
        _Pragma("unroll") for (int mt = 0; mt < 2; ++mt) { Sacc[mt] = Sacc[mt] * F.dl; \
            Sacc[mt] = __builtin_amdgcn_mfma_f32_16x16x32_bf16(F.kt[mt][0], v0, Sacc[mt], 0, 0, 0); Sacc[mt] = __builtin_amdgcn_mfma_f32_16x16x32_bf16(F.kt[mt][1], v1, Sacc[mt], 0, 0, 0); \
            v2u w; w.x = pk2(Sacc[mt][0], Sacc[mt][1]); w.y = pk2(Sacc[mt][2], Sacc[mt][3]); *(LAS v2u*)(ST + (cur ^ 1) * 16 * STP + c * STP + 16 * (2 * wi + mt) + 4 * g) = w; } \
        LDS_BAR(); } while (0)
    for (int n = 0; n < T / 64; n += 2) {
        gdn_load(F1, p, (n + 1) * 4 + h, off128, off64, offk, offu);
        GDN_STEP(F0, n);
        gdn_load(F0, p, ((n + 2 < T / 64) ? n + 2 : n) * 4 + h, off128, off64, offk, offu);
        GDN_STEP(F1, n + 1);
    }
#undef GDN_STEP
}

constexpr int SEQ_UOFF = 132096;
constexpr int GI_NW = 0, GI_QG = 8704, GI_AT = 17408, GI_KT = 22016, GI_SZ = 31232;
struct GdnStage { v4u r[7]; float u[4]; float dl; };
__device__ __forceinline__ void gdn_stage_load(GdnStage& Sg, const Params& p, int item, int tid, int offu) {
    const bf16* GNW = (const bf16*)(p.ws + WS_GNW) + (size_t)item * 8192; const bf16* GQG = (const bf16*)(p.ws + WS_GQG) + (size_t)item * 8192;
    const bf16* GAT = (const bf16*)(p.ws + WS_GAT) + (size_t)item * 4096; const bf16* GKT = (const bf16*)(p.ws + WS_GKT) + (size_t)item * 8192; const float* GU = (const float*)(p.ws + WS_GU) + (size_t)item * 8192;
    Sg.r[0] = *(const v4u*)(GNW + 8 * tid); Sg.r[1] = *(const v4u*)(GNW + 8 * (tid + 512)); Sg.r[2] = *(const v4u*)(GQG + 8 * tid); Sg.r[3] = *(const v4u*)(GQG + 8 * (tid + 512));
    Sg.r[4] = *(const v4u*)(GAT + 8 * tid); Sg.r[5] = *(const v4u*)(GKT + 8 * tid); Sg.r[6] = *(const v4u*)(GKT + 8 * (tid + 512));
#pragma unroll
    for (int r = 0; r < 4; ++r) Sg.u[r] = GU[offu + r * 128];
    Sg.dl = ((const float*)(p.ws + WS_GDL))[item];
}
__device__ __forceinline__ void gdn_stage_write(const GdnStage& Sg, LAS unsigned short* img, int tid) {
    { const int p0 = tid, p1 = tid + 512;
      *(LAS v4u*)(img + GI_NW + (p0 >> 4) * 136 + 8 * (p0 & 15)) = Sg.r[0]; *(LAS v4u*)(img + GI_NW + (p1 >> 4) * 136 + 8 * (p1 & 15)) = Sg.r[1];
      *(LAS v4u*)(img + GI_QG + (p0 >> 4) * 136 + 8 * (p0 & 15)) = Sg.r[2]; *(LAS v4u*)(img + GI_QG + (p1 >> 4) * 136 + 8 * (p1 & 15)) = Sg.r[3];
      *(LAS v4u*)(img + GI_AT + (p0 >> 3) * 72 + 8 * (p0 & 7)) = Sg.r[4];
      *(LAS v4u*)(img + GI_KT + (p0 >> 3) * 72 + 8 * (p0 & 7)) = Sg.r[5]; *(LAS v4u*)(img + GI_KT + (p1 >> 3) * 72 + 8 * (p1 & 7)) = Sg.r[6]; }
}
__device__ __forceinline__ void gdn_seq2(const Params& p, LAS unsigned char* lds, int wgi, int tid, int wave, int lane) {
    const int h = wgi >> 2, sl = 2 * (wgi & 3) + (wave >> 2), wi = wave & 3, g = lane >> 4, c = lane & 15;
    LAS unsigned short* IMG = (LAS unsigned short*)lds;
    LAS unsigned short* ST = (LAS unsigned short*)(lds + SEQ_UOFF + (wave >> 2) * 12288);
    LAS unsigned short* VNT = ST + 2 * 16 * STP;
    float* GO = (float*)(p.ws + WS_GO);
    const int offu = (16 * wi + 4 * g) * 128 + 16 * sl + c;
#pragma unroll
    for (int mt = 0; mt < 2; ++mt) *(LAS v2u*)(ST + c * STP + 16 * (2 * wi + mt) + 4 * g) = (v2u){0u, 0u};
    pg8::f32x4 Sacc[2] = {{0.f, 0.f, 0.f, 0.f}, {0.f, 0.f, 0.f, 0.f}};
    GdnStage A, B;
    gdn_stage_load(A, p, h, tid, offu); gdn_stage_write(A, IMG, tid);
    gdn_stage_load(B, p, 4 + h, tid, offu);
    LDS_BAR();
    constexpr int NCH = T / 64;
#define GDN_STEP2(X, Y, n_) do { const int cur = (n_) & 1; const LAS unsigned short* im = IMG + cur * GI_SZ; bf16x8_t sf[4]; \
        _Pragma("unroll") for (int ks = 0; ks < 4; ++ks) sf[ks] = *(const LAS bf16x8_t*)(ST + cur * 16 * STP + c * STP + 32 * ks + 8 * g); \
        pg8::f32x4 vn = {X.u[0], X.u[1], X.u[2], X.u[3]}; const float dl = X.dl; \
        _Pragma("unroll") for (int ks = 0; ks < 4; ++ks) vn = __builtin_amdgcn_mfma_f32_16x16x32_bf16(*(const LAS bf16x8_t*)(im + GI_NW + (16 * wi + c) * 136 + 32 * ks + 8 * g), sf[ks], vn, 0, 0, 0); \
        { v2u w; w.x = pk2(vn[0], vn[1]); w.y = pk2(vn[2], vn[3]); *(LAS v2u*)(VNT + c * VNP + 16 * wi + 4 * g) = w; } \
        pg8::f32x4 o = {0.f, 0.f, 0.f, 0.f}; \
        _Pragma("unroll") for (int ks = 0; ks < 4; ++ks) o = __builtin_amdgcn_mfma_f32_16x16x32_bf16(*(const LAS bf16x8_t*)(im + GI_QG + (16 * wi + c) * 136 + 32 * ks + 8 * g), sf[ks], o, 0, 0, 0); \
        LDS_BAR(); \
        gdn_stage_load(X, p, (((n_) + 2 < NCH) ? (n_) + 2 : (n_)) * 4 + h, tid, offu); \
        const bf16x8_t v0 = *(const LAS bf16x8_t*)(VNT + c * VNP + 8 * g), v1 = *(const LAS bf16x8_t*)(VNT + c * VNP + 32 + 8 * g); \
        o = __builtin_amdgcn_mfma_f32_16x16x32_bf16(*(const LAS bf16x8_t*)(im + GI_AT + (16 * wi + c) * 72 + 8 * g), v0, o, 0, 0, 0); \
        o = __builtin_amdgcn_mfma_f32_16x16x32_bf16(*(const LAS bf16x8_t*)(im + GI_AT + (16 * wi + c) * 72 + 32 + 8 * g), v1, o, 0, 0, 0); \
        { const size_t tb = (size_t)(n_) * 64 + 16 * wi + 4 * g; _Pragma("unroll") for (int r = 0; r < 4; ++r) GO[(tb + r) * BW + h * 128 + 16 * sl + c] = o[r]; } \
        _Pragma("unroll") for (int mt = 0; mt < 2; ++mt) { Sacc[mt] = Sacc[mt] * dl; \
            Sacc[mt] = __builtin_amdgcn_mfma_f32_16x16x32_bf16(*(const LAS bf16x8_t*)(im + GI_KT + (16 * (2 * wi + mt) + c) * 72 + 8 * g), v0, Sacc[mt], 0, 0, 0); \
            Sacc[mt] = __builtin_amdgcn_mfma_f32_16x16x32_bf16(*(const LAS bf16x8_t*)(im + GI_KT + (16 * (2 * wi + mt) + c) * 72 + 32 + 8 * g), v1, Sacc[mt], 0, 0, 0); \
            v2u w; w.x = pk2(Sacc[mt][0], Sacc[mt][1]); w.y = pk2(Sacc[mt][2], Sacc[mt][3]); *(LAS v2u*)(ST + (cur ^ 1) * 16 * STP + c * STP + 16 * (2 * wi + mt) + 4 * g) = w; } \
        gdn_stage_write(Y, IMG + (cur ^ 1) * GI_SZ, tid); \
        LDS_BAR(); } while (0)
    for (int n = 0; n < NCH; n += 2) { GDN_STEP2(A, B, n); GDN_STEP2(B, A, n + 1); }
#undef GDN_STEP2
}
constexpr int MI_Q = 0, MI_S = 4608, MI_K = 9216, MI_SZ = 13824;
struct MlStage { v4u r[3]; bf16x8_t vt[2]; float fl; };
__device__ __forceinline__ void ml_stage_load(MlStage& Sg, const Params& p, int item, int tid, int offV) {
    const bf16* MQ = (const bf16*)(p.ws + WS_MQ) + (size_t)item * 4096; const bf16* MS = (const bf16*)(p.ws + WS_MS) + (size_t)item * 4096; const bf16* MK = (const bf16*)(p.ws + WS_MK) + (size_t)item * 4096;
    const bf16* MV = (const bf16*)(p.ws + WS_MV) + (size_t)item * 9216;
    Sg.r[0] = *(const v4u*)(MQ + 8 * tid); Sg.r[1] = *(const v4u*)(MS + 8 * tid); Sg.r[2] = *(const v4u*)(MK + 8 * tid);
    Sg.vt[0] = *(const bf16x8_t*)(MV + offV); Sg.vt[1] = *(const bf16x8_t*)(MV + offV + 32);
    Sg.fl = ((const float*)(p.ws + WS_MFL))[item];
}
__device__ __forceinline__ void ml_stage_write(const MlStage& Sg, LAS unsigned short* img, int tid) {
    const int o = (tid >> 3) * 72 + 8 * (tid & 7);
    *(LAS v4u*)(img + MI_Q + o) = Sg.r[0]; *(LAS v4u*)(img + MI_S + o) = Sg.r[1]; *(LAS v4u*)(img + MI_K + o) = Sg.r[2];
}
__device__ __forceinline__ void ml_seq2(const Params& p, LAS unsigned char* lds, int wgi, int tid, int wave, int lane) {
    const int h = wgi / 5, sl0 = 2 * (wgi % 5) + (wave >> 2), wi = wave & 3, g = lane >> 4, c = lane & 15;
    const bool real = sl0 < 9; const int sl = real ? sl0 : 8;
    LAS unsigned short* IMG = (LAS unsigned short*)lds;
    LAS unsigned short* CT = (LAS unsigned short*)(lds + SEQ_UOFF + (wave >> 2) * 8192);
    float* HO = (float*)(p.ws + WS_HO); float* HDEN = (float*)(p.ws + WS_HDEN);
    const int offV = (16 * sl + c) * 64 + 8 * g;
    *(LAS v2u*)(CT + c * 72 + 16 * wi + 4 * g) = (v2u){0u, 0u};
    pg8::f32x4 Cacc = {0.f, 0.f, 0.f, 0.f};
    MlStage A, B;
    ml_stage_load(A, p, h, tid, offV); ml_stage_write(A, IMG, tid);
    ml_stage_load(B, p, 4 + h, tid, offV);
    LDS_BAR();
    constexpr int NCH = T / 64;
#define ML_STEP2(X, Y, n_) do { const int cur = (n_) & 1; const LAS unsigned short* im = IMG + cur * MI_SZ; const int ro = (16 * wi + c) * 72 + 8 * g; \
        const bf16x8_t c0 = *(const LAS bf16x8_t*)(CT + cur * 16 * 72 + c * 72 + 8 * g), c1 = *(const LAS bf16x8_t*)(CT + cur * 16 * 72 + c * 72 + 32 + 8 * g); \
        const bf16x8_t vt0 = X.vt[0], vt1 = X.vt[1]; const float fl = X.fl; \
        pg8::f32x4 num = {0.f, 0.f, 0.f, 0.f}; \
        num = __builtin_amdgcn_mfma_f32_16x16x32_bf16(*(const LAS bf16x8_t*)(im + MI_Q + ro), c0, num, 0, 0, 0); num = __builtin_amdgcn_mfma_f32_16x16x32_bf16(*(const LAS bf16x8_t*)(im + MI_Q + ro + 32), c1, num, 0, 0, 0); \
        num = __builtin_amdgcn_mfma_f32_16x16x32_bf16(*(const LAS bf16x8_t*)(im + MI_S + ro), vt0, num, 0, 0, 0); num = __builtin_amdgcn_mfma_f32_16x16x32_bf16(*(const LAS bf16x8_t*)(im + MI_S + ro + 32), vt1, num, 0, 0, 0); \
        Cacc = Cacc * fl; \
        Cacc = __builtin_amdgcn_mfma_f32_16x16x32_bf16(*(const LAS bf16x8_t*)(im + MI_K + ro), vt0, Cacc, 0, 0, 0); Cacc = __builtin_amdgcn_mfma_f32_16x16x32_bf16(*(const LAS bf16x8_t*)(im + MI_K + ro + 32), vt1, Cacc, 0, 0, 0); \
        ml_stage_load(X, p, (((n_) + 2 < NCH) ? (n_) + 2 : (n_)) * 4 + h, tid, offV); \
        { v2u w; w.x = pk2(Cacc[0], Cacc[1]); w.y = pk2(Cacc[2], Cacc[3]); *(LAS v2u*)(CT + (cur ^ 1) * 16 * 72 + c * 72 + 16 * wi + 4 * g) = w; } \
        { const size_t tb = (size_t)(n_) * 64 + 16 * wi + 4 * g; \
          if (sl < 8) { _Pragma("unroll") for (int r = 0; r < 4; ++r) HO[(tb + r) * BW + h * 128 + 16 * sl + c] = num[r]; } \
          else if (c == 0 && real) { _Pragma("unroll") for (int r = 0; r < 4; ++r) HDEN[(tb + r) * 4 + h] = num[r]; } } \
        ml_stage_write(Y, IMG + (cur ^ 1) * MI_SZ, tid); \
        LDS_BAR(); } while (0)
    for (int n = 0; n < NCH; n += 2) { ML_STEP2(A, B, n); ML_STEP2(B, A, n + 1); }
#undef ML_STEP2
}

__device__ __forceinline__ void mixer_gmlp_item(const Params& p, int l, LAS unsigned char* lds, int item, int tid, int wave, int lane) {
    const int chunk = item >> 2, g = item & 3; const size_t tok0 = (size_t)chunk * 128;
    const bf16* Z = (const bf16*)(p.ws + WS_Z); bf16* BR1 = (bf16*)(p.ws + WS_BR) + 1 * BW;
    const float* ng = p.in[I_GMNG] + l * BW; const float* nb = p.in[I_GMNB] + l * BW;
    const float* wsp = p.in[I_GMWS] + ((size_t)(l * 4 + g) * 128) * 128; const float* bsp = p.in[I_GMBS] + (l * 4 + g) * 128;
    LAS float* vn = (LAS float*)lds;
    for (int r = 0; r < 16; ++r) { const int tk = wave * 16 + r;
        const v4u raw = *(const v4u*)(Z + (tok0 + tk) * ZC + ZC_GMV + 8 * lane); float x[8]; unpack8(raw, x); float s = 0.f;
#pragma unroll
        for (int i = 0; i < 8; ++i) { x[i] = gelu_tanh(x[i]); s += x[i]; }
        const float mean = wave_sum(s) * (1.f / 512.f); float ss = 0.f;
#pragma unroll
        for (int i = 0; i < 8; ++i) { x[i] -= mean; ss += x[i] * x[i]; }
        const float rstd = rsqrtf(wave_sum(ss) * (1.f / 512.f) + LN_EPS);
        if ((lane >> 4) == g) { const int cl = 8 * (lane & 15);
#pragma unroll
            for (int i = 0; i < 8; ++i) vn[tk * 128 + cl + i] = x[i] * rstd * ng[8 * lane + i] + nb[8 * lane + i]; }
    }
    __syncthreads();
    const int t = tid >> 2, cq = tid & 3; float acc[32];
#pragma unroll
    for (int i = 0; i < 32; ++i) acc[i] = 0.f;
    const float* wrow = wsp + (size_t)t * 128;
    for (int s = 0; s <= t; ++s) { const float w = wrow[s]; const LAS float* row = vn + s * 128 + cq * 32;
#pragma unroll
        for (int i4 = 0; i4 < 8; ++i4) { const v4f a = *(const LAS v4f*)(row + 4 * i4); acc[4 * i4] += w * a.x; acc[4 * i4 + 1] += w * a.y; acc[4 * i4 + 2] += w * a.z; acc[4 * i4 + 3] += w * a.w; } }
    const float bias = bsp[t];
#pragma unroll
    for (int i8 = 0; i8 < 4; ++i8) { const v4u raw = *(const v4u*)(Z + (tok0 + t) * ZC + ZC_GMU + g * 128 + cq * 32 + 8 * i8); float u[8]; unpack8(raw, u); float o[8];
#pragma unroll
        for (int i = 0; i < 8; ++i) o[i] = gelu_tanh(u[i]) * (acc[8 * i8 + i] + bias);
        v4u w; w.x = pk2(o[0], o[1]); w.y = pk2(o[2], o[3]); w.z = pk2(o[4], o[5]); w.w = pk2(o[6], o[7]);
        *(v4u*)(BR1 + (tok0 + t) * BRW + g * 128 + cq * 32 + 8 * i8) = w; }
    __syncthreads();
}

__device__ __forceinline__ void vt_item(const Params& p, LAS unsigned char* lds, int item, int tid) {
    const int h = item & 3, n = item >> 2; const size_t t0 = (size_t)n * 64;
    const bf16* Z = (const bf16*)(p.ws + WS_Z); bf16* VT = (bf16*)(p.ws + WS_VT);
    LAS unsigned short* vs = (LAS unsigned short*)lds;
#pragma unroll
    for (int r = 0; r < 2; ++r) { const int idx = tid + 512 * r, tk = idx >> 4, c8 = idx & 15;
        *(LAS v4u*)(vs + tk * 136 + 8 * c8) = *(const v4u*)(Z + (t0 + tk) * ZC + ZC_SBV + h * 128 + 8 * c8); }
    __syncthreads();
    { const int d = tid >> 2, jq = tid & 3; unsigned w[8];
#pragma unroll
      for (int x = 0; x < 8; ++x) w[x] = (unsigned)vs[(16 * jq + 2 * x) * 136 + d] | ((unsigned)vs[(16 * jq + 2 * x + 1) * 136 + d] << 16);
      bf16* dst = VT + ((size_t)h * 128 + d) * T + t0 + 16 * jq;
      *(v4u*)dst = (v4u){w[0], w[1], w[2], w[3]}; *(v4u*)(dst + 8) = (v4u){w[4], w[5], w[6], w[7]}; }
    __syncthreads();
}
constexpr int KTP = 136, VTP = 72;
__device__ __forceinline__ void sb_unit(const Params& p, LAS unsigned char* lds, int unit, int tid, int wave, int lane) {
    const int h = unit >> 6, q0 = (unit & 63) * 128, g = lane >> 4, c = lane & 15; const int qrow = q0 + 16 * wave + c;
    const bf16* Z = (const bf16*)(p.ws + WS_Z); const bf16* VT = (const bf16*)(p.ws + WS_VT) + (size_t)h * 128 * T; bf16* BR0 = (bf16*)(p.ws + WS_BR);
    LAS unsigned short* Kt = (LAS unsigned short*)lds;
    LAS unsigned short* Vt = Kt + 2 * 64 * KTP;
    LAS int* flags = (LAS int*)(Vt + 2 * 128 * VTP);
    bf16x8_t qf[4];
#pragma unroll
    for (int ks = 0; ks < 4; ++ks) qf[ks] = *(const bf16x8_t*)(Z + (size_t)qrow * ZC + ZC_SBQ + h * 128 + 32 * ks + 8 * g);
    pg8::f32x4 acc[8];
#pragma unroll
    for (int dt = 0; dt < 8; ++dt) acc[dt] = (pg8::f32x4){0.f, 0.f, 0.f, 0.f};
    float racc = 0.f;
    v4u kr[2], vr[2];
    const int jt = (q0 >> 6) + 1;
#define SB_GLOAD(j_) do { _Pragma("unroll") for (int r = 0; r < 2; ++r) { const int idx = tid + 512 * r; \
        kr[r] = *(const v4u*)(Z + (size_t)(64 * (j_) + (idx >> 4)) * ZC + ZC_SBK + h * 128 + 8 * (idx & 15)); \
        vr[r] = *(const v4u*)(VT + (size_t)(idx >> 3) * T + 64 * (j_) + 8 * (idx & 7)); } } while (0)
#define SB_LWRITE(b_) do { _Pragma("unroll") for (int r = 0; r < 2; ++r) { const int idx = tid + 512 * r; \
        *(LAS v4u*)(Kt + (b_) * 64 * KTP + (idx >> 4) * KTP + 8 * (idx & 15)) = kr[r]; *(LAS v4u*)(Vt + (b_) * 128 * VTP + (idx >> 3) * VTP + 8 * (idx & 7)) = vr[r]; } } while (0)
    LDS_BAR();
    SB_GLOAD(jt); SB_LWRITE(0);
    LDS_BAR();
    for (int j = jt, it = 0; j >= 0; --j, ++it) {
        const int cur = it & 1;
        SB_GLOAD(j > 0 ? j - 1 : 0);
        const bool wdone = __all(racc > 104.f);
        if (64 * j < q0 + 16 * wave + 15 && !wdone) {
            const LAS unsigned short* Kc = Kt + cur * 64 * KTP; const LAS unsigned short* Vc = Vt + cur * 128 * VTP;
            pg8::f32x4 z[4];
#pragma unroll
            for (int s = 0; s < 4; ++s) { z[s] = (pg8::f32x4){0.f, 0.f, 0.f, 0.f};
#pragma unroll
                for (int ks = 0; ks < 4; ++ks) z[s] = __builtin_amdgcn_mfma_f32_16x16x32_bf16(*(const LAS bf16x8_t*)(Kc + (16 * s + c) * KTP + 32 * ks + 8 * g), qf[ks], z[s], 0, 0, 0); }
            float sp[4][4], t[4], xs[4]; bool mk[4][4];
#pragma unroll
            for (int s = 0; s < 4; ++s) { t[s] = 0.f;
#pragma unroll
                for (int r = 0; r < 4; ++r) { const int key = 64 * j + 16 * s + 4 * g + r; mk[s][r] = key < qrow; const float zz = z[s][r] * 0.08838834764831845f; z[s][r] = zz;
                    sp[s][r] = mk[s][r] ? softplusf_(zz) : 0.f; t[s] += sp[s][r]; } }
            float grand = 0.f, higher[4];
#pragma unroll
            for (int s = 3; s >= 0; --s) { float x = t[s]; float y = __shfl(x, lane + 16); x += (g < 3) ? y : 0.f; y = __shfl(x, lane + 32); x += (g < 2) ? y : 0.f;
                xs[s] = x - t[s];
                const float tot = __shfl(x, c); higher[s] = grand; grand += tot; }
            bf16x8_t pf[2];
#pragma unroll
            for (int s = 0; s < 4; ++s) { float a[4]; float e = 0.f;
#pragma unroll
                for (int r = 3; r >= 0; --r) { const float la = z[s][r] - sp[s][r] - (racc + higher[s] + xs[s] + e); a[r] = mk[s][r] ? __expf(la) : 0.f; e += sp[s][r]; }
                const unsigned w0 = pk2(a[0], a[1]), w1 = pk2(a[2], a[3]);
                if ((s & 1) == 0) { pf[s >> 1][0] = (short)(w0 & 0xffff); pf[s >> 1][1] = (short)(w0 >> 16); pf[s >> 1][2] = (short)(w1 & 0xffff); pf[s >> 1][3] = (short)(w1 >> 16); }
                else              { pf[s >> 1][4] = (short)(w0 & 0xffff); pf[s >> 1][5] = (short)(w0 >> 16); pf[s >> 1][6] = (short)(w1 & 0xffff); pf[s >> 1][7] = (short)(w1 >> 16); } }
            racc += grand;
#pragma unroll
            for (int dt = 0; dt < 8; ++dt)
#pragma unroll
                for (int k2 = 0; k2 < 2; ++k2) { const v2u lo = *(const LAS v2u*)(Vc + (16 * dt + c) * VTP + 32 * k2 + 4 * g), hi = *(const LAS v2u*)(Vc + (16 * dt + c) * VTP + 32 * k2 + 16 + 4 * g);
                    const v4u vv = (v4u){lo.x, lo.y, hi.x, hi.y};
                    acc[dt] = __builtin_amdgcn_mfma_f32_16x16x32_bf16(__builtin_bit_cast(bf16x8_t, vv), pf[k2], acc[dt], 0, 0, 0); }
        }
        const bool wd2 = __all(racc > 104.f);
        if (lane == 0) flags[cur * 8 + wave] = wd2 ? 1 : 0;
        SB_LWRITE(cur ^ 1);
        LDS_BAR();
        int alld = 1;
#pragma unroll
        for (int w = 0; w < 8; ++w) alld &= flags[cur * 8 + w];
        if (alld) break;
    }
#undef SB_GLOAD
#undef SB_LWRITE
#pragma unroll
    for (int dt = 0; dt < 8; ++dt) { v2u w; w.x = pk2(acc[dt][0], acc[dt][1]); w.y = pk2(acc[dt][2], acc[dt][3]); *(v2u*)(BR0 + (size_t)qrow * BRW + h * 128 + 16 * dt + 4 * g) = w; }
}

__device__ __forceinline__ void phase_mixers(const Params& p, int l, LAS unsigned char* lds, int wg, int G, int tid, int wave, int lane, const XcdBarrier& bar) {
#if defined(PROBE_SPLIT)
    if (wg < 16) gdn_seq2(p, lds, wg, tid, wave, lane); else if (wg < 36) ml_seq2(p, lds, wg - 16, tid, wave, lane);
    xcd_barrier(bar);
    const int w2 = wg, G2 = G;
#else
    if (wg < 16) { gdn_seq2(p, lds, wg, tid, wave, lane); return; }
    if (wg < 36) { ml_seq2(p, lds, wg - 16, tid, wave, lane); return; }
    const int w2 = wg - 36, G2 = G - 36;
#endif
    for (int it = w2; it < 256; it += G2) mixer_gmlp_item(p, l, lds, it, tid, wave, lane);
    for (int it = w2; it < 256; it += G2) sb_unit(p, lds, it, tid, wave, lane);
#if !defined(PROBE_CONV0)
    __syncthreads();
    phase_convert<1>(p, l, lds, w2 * 8 + wave, G2 * 8, wave, lane);
#endif
}

__device__ __forceinline__ void phase_post(const Params& p, int l, int gw, int NGW, int lane) {
    const bf16* Z = (const bf16*)(p.ws + WS_Z); const float* GO = (const float*)(p.ws + WS_GO); const float* HO = (const float*)(p.ws + WS_HO); const float* HDEN = (const float*)(p.ws + WS_HDEN);
    bf16* BR2 = (bf16*)(p.ws + WS_BR) + 2 * BW; bf16* BR3 = (bf16*)(p.ws + WS_BR) + 3 * BW;
    const float* gng = p.in[I_GDNNG] + l * 128; const float* mng = p.in[I_MLNG] + l * BW;
    for (int t = gw; t < T; t += NGW) {
        {   const v4f a0 = *(const v4f*)(GO + (size_t)t * BW + 8 * lane), a1 = *(const v4f*)(GO + (size_t)t * BW + 8 * lane + 4); float o[8] = {a0.x, a0.y, a0.z, a0.w, a1.x, a1.y, a1.z, a1.w}; float ss = 0.f;
#pragma unroll
            for (int i = 0; i < 8; ++i) ss += o[i] * o[i];
            const float r = rsqrtf(sum16(ss) * (1.f / 128.f) + LN_EPS);
            const v4u graw = *(const v4u*)(Z + (size_t)t * ZC + ZC_GDNG + 8 * lane); float gt[8]; unpack8(graw, gt);
#pragma unroll
            for (int i = 0; i < 8; ++i) o[i] = o[i] * r * gng[(8 * lane + i) & 127] * siluf_(gt[i]);
            v4u w; w.x = pk2(o[0], o[1]); w.y = pk2(o[2], o[3]); w.z = pk2(o[4], o[5]); w.w = pk2(o[6], o[7]); *(v4u*)(BR2 + (size_t)t * BRW + 8 * lane) = w; }
        {   const v4f a0 = *(const v4f*)(HO + (size_t)t * BW + 8 * lane), a1 = *(const v4f*)(HO + (size_t)t * BW + 8 * lane + 4); float o[8] = {a0.x, a0.y, a0.z, a0.w, a1.x, a1.y, a1.z, a1.w}; float ss = 0.f;
            const float dn = 1.f / fmaxf(fabsf(HDEN[(size_t)t * 4 + (lane >> 4)]), 1.f);
#pragma unroll
            for (int i = 0; i < 8; ++i) { o[i] *= dn; ss += o[i] * o[i]; }
            const float r = rsqrtf(sum16(ss) * (1.f / 128.f) + LN_EPS);
            const v4u graw = *(const v4u*)(Z + (size_t)t * ZC + ZC_MLO + 8 * lane); float gt[8]; unpack8(graw, gt);
#pragma unroll
            for (int i = 0; i < 8; ++i) o[i] = o[i] * r * mng[8 * lane + i] * sigmoidf_(gt[i]);
            v4u w; w.x = pk2(o[0], o[1]); w.y = pk2(o[2], o[3]); w.z = pk2(o[4], o[5]); w.w = pk2(o[6], o[7]); *(v4u*)(BR3 + (size_t)t * BRW + 8 * lane) = w; }
    }
}

__device__ __forceinline__ void ln_row(const float* yrow, const float* g, const float* b, int lane, v4f (&v)[8]) {
    const v4f* yr = (const v4f*)yrow + lane; float s = 0.f;
#pragma unroll
    for (int j = 0; j < 8; ++j) { v[j] = yr[64 * j]; s += (v[j].x + v[j].y) + (v[j].z + v[j].w); }
    const float mean = wave_sum(s) * (1.f / D); float s2 = 0.f;
#pragma unroll
    for (int j = 0; j < 8; ++j) { v[j] = v[j] - mean; s2 += (v[j].x * v[j].x + v[j].y * v[j].y) + (v[j].z * v[j].z + v[j].w * v[j].w); }
    const float rstd = rsqrtf(wave_sum(s2) * (1.f / D) + LN_EPS);
#pragma unroll
    for (int j = 0; j < 8; ++j) { const v4f gg = ((const v4f*)g)[lane + 64 * j], bb = ((const v4f*)b)[lane + 64 * j]; v[j] = v[j] * rstd * gg + bb; }
}
constexpr int RT_XP = 2052;
constexpr int RT_TAB = 131072 + 1024;
__device__ __forceinline__ void phase_ln1_router(const Params& p, int l, LAS unsigned char* lds, int wg, int G, int wave, int lane, int cnt_shift = 0) {
    const float* Y = (const float*)(p.ws + WS_Y); float* X1 = (float*)(p.ws + WS_X1); bf16* X1B = (bf16*)(p.ws + WS_X1B); int* LIST = (int*)(p.ws + WS_LIST); float* WL = (float*)(p.ws + WS_WL); unsigned* SLOT = (unsigned*)(p.ws + WS_SLOT);
    unsigned* cnt = (unsigned*)(p.ws + WS_CTL) + CW_CNT + l * 4096 + cnt_shift;
    const float* g1 = p.in[I_LN1G] + (size_t)l * D; const float* b1 = p.in[I_LN1B] + (size_t)l * D;
    const float* wr = p.in[I_WR] + (size_t)l * D * NE; const float rbias = p.in[I_RB][l * NE + lane];
    LAS float* xt = (LAS float*)lds;
    LAS float* part = (LAS float*)lds;
    LAS unsigned char* selm = lds + RT_TAB; LAS unsigned char* rkm = selm + 4096; LAS float* wtm = (LAS float*)(rkm + 4096); LAS unsigned* basem = (LAS unsigned*)(wtm + 4096);
    const int n_l = lane & 15, kq = lane >> 4;
    int gi = 0;
    for (int tg = wg; tg < T / 16; tg += G, ++gi) {
        {   v4f va[8], vb[8]; const size_t m0 = (size_t)tg * 16 + 2 * wave;
            const v4f* ya = (const v4f*)(Y + m0 * D) + lane; const v4f* yb = (const v4f*)(Y + (m0 + 1) * D) + lane;
#pragma unroll
            for (int j = 0; j < 8; ++j) { va[j] = ya[64 * j]; vb[j] = yb[64 * j]; }
            float sa = 0.f, sb = 0.f;
#pragma unroll
            for (int j = 0; j < 8; ++j) { sa += (va[j].x + va[j].y) + (va[j].z + va[j].w); sb += (vb[j].x + vb[j].y) + (vb[j].z + vb[j].w); }
            const float ma = wave_sum(sa) * (1.f / D), mb = wave_sum(sb) * (1.f / D); float qa = 0.f, qb = 0.f;
#pragma unroll
            for (int j = 0; j < 8; ++j) { va[j] = va[j] - ma; vb[j] = vb[j] - mb; qa += (va[j].x * va[j].x + va[j].y * va[j].y) + (va[j].z * va[j].z + va[j].w * va[j].w); qb += (vb[j].x * vb[j].x + vb[j].y * vb[j].y) + (vb[j].z * vb[j].z + vb[j].w * vb[j].w); }
            const float ra = rsqrtf(wave_sum(qa) * (1.f / D) + LN_EPS), rb = rsqrtf(wave_sum(qb) * (1.f / D) + LN_EPS);
#pragma unroll
            for (int j = 0; j < 8; ++j) { const v4f gg = ((const v4f*)g1)[lane + 64 * j], bb = ((const v4f*)b1)[lane + 64 * j]; va[j] = va[j] * ra * gg + bb; vb[j] = vb[j] * rb * gg + bb; }
#pragma unroll
            for (int rr = 0; rr < 2; ++rr) { const size_t m = m0 + rr; v4f* xo = (v4f*)(X1 + m * D) + lane;
#pragma unroll
                for (int j = 0; j < 8; ++j) { const v4f v = rr ? vb[j] : va[j]; xo[64 * j] = v;
#if MOE_UP_FP8
                    { unsigned w = 0; w = __builtin_amdgcn_cvt_pk_fp8_f32(v.x, v.y, w, false); w = __builtin_amdgcn_cvt_pk_fp8_f32(v.z, v.w, w, true); ((unsigned*)((unsigned char*)X1B + m * D))[lane + 64 * j] = w; }
#else
                    { v2u o; o.x = pk2(v.x, v.y); o.y = pk2(v.z, v.w); ((v2u*)(X1B + m * D))[lane + 64 * j] = o; }
#endif
                    *(LAS v4f*)(xt + (2 * wave + rr) * RT_XP + 4 * lane + 256 * j) = v; } } }
        __syncthreads();
        {   pg8::f32x4 acc[4];
#pragma unroll
            for (int i = 0; i < 4; ++i) acc[i] = (pg8::f32x4){0.f, 0.f, 0.f, 0.f};
            const float* wb = wr + (size_t)(256 * wave + 4 * kq) * NE + 4 * n_l;
            const LAS float* xa = xt + n_l * RT_XP + 256 * wave + 4 * kq;
            v4f bwa[16], bwb[16];
#define RT_LOADW(dst, sb_) do { _Pragma("unroll") for (int q = 0; q < 16; ++q) dst[q] = *(const v4f*)(wb + (size_t)(16 * (4 * (sb_) + (q >> 2)) + (q & 3)) * NE); } while (0)
#define RT_MMA(src, sb_) do { _Pragma("unroll") for (int sg = 0; sg < 4; ++sg) { const v4f a4 = *(const LAS v4f*)(xa + 16 * (4 * (sb_) + sg)); \
                _Pragma("unroll") for (int c = 0; c < 4; ++c) { const v4f b4 = src[sg * 4 + c]; const float a = c == 0 ? a4.x : c == 1 ? a4.y : c == 2 ? a4.z : a4.w; \
                    acc[0] = __builtin_amdgcn_mfma_f32_16x16x4f32(a, b4.x, acc[0], 0, 0, 0); acc[1] = __builtin_amdgcn_mfma_f32_16x16x4f32(a, b4.y, acc[1], 0, 0, 0); \
                    acc[2] = __builtin_amdgcn_mfma_f32_16x16x4f32(a, b4.z, acc[2], 0, 0, 0); acc[3] = __builtin_amdgcn_mfma_f32_16x16x4f32(a, b4.w, acc[3], 0, 0, 0); } } } while (0)
            RT_LOADW(bwa, 0);
#pragma unroll 1
            for (int h = 0; h < 2; ++h) {
                RT_LOADW(bwb, 1); RT_MMA(bwa, 0);
                if (h == 0) RT_LOADW(bwa, 2);
                RT_MMA(bwb, 1);
                wb += (size_t)128 * NE; xa += 128; asm volatile("" : "+v"(wb));
            }
#undef RT_LOADW
#undef RT_MMA
            __syncthreads();
#pragma unroll
            for (int j = 0; j < 4; ++j) *(LAS v4f*)(part + (wave * 16 + 4 * kq + j) * 64 + 4 * n_l) = (v4f){acc[0][j], acc[1][j], acc[2][j], acc[3][j]}; }
        __syncthreads();
#pragma unroll 1
        for (int rr = 0; rr < 2; ++rr) { const int lr = wave + 8 * rr; float logit = 0.f;
#pragma unroll
            for (int w = 0; w < 8; ++w) logit += part[(w * 16 + lr) * 64 + lane];
            const float s = sigmoidf_(logit), biased = s + rbias;
            const float m1 = max8(biased); const float li = (float)(lane & 7);
            const float first = min8(biased == m1 ? li : 8.f);
            const float m2 = max8(li == first ? -INFINITY : biased);
            const float gs = m1 + m2; const int myg = lane >> 3; int grank = 0;
#pragma unroll
            for (int g2 = 0; g2 < 8; ++g2) { const float o = __builtin_bit_cast(float, __builtin_amdgcn_readlane(__builtin_bit_cast(int, gs), g2 * 8)); grank += (o > gs || (o == gs && g2 < myg)) ? 1 : 0; }
            const float masked = grank < 4 ? biased : -INFINITY; int rank = 0;
#pragma unroll
            for (int e2 = 0; e2 < 64; ++e2) { const float o = __builtin_bit_cast(float, __builtin_amdgcn_readlane(__builtin_bit_cast(int, masked), e2)); rank += (o > masked || (o == masked && e2 < lane)) ? 1 : 0; }
            const float wsel = rank < 6 ? s : 0.f; const float tot = wave_sum(wsel);
            const int ri = gi * 16 + lr;
            selm[ri * 64 + lane] = (rank < 6) ? 1 : 0; rkm[ri * 64 + lane] = (unsigned char)rank; wtm[ri * 64 + lane] = wsel / tot * 2.5f; }
        __syncthreads();
    }
    const int nrows = gi * 16;
    if (wave == 0) { unsigned n = 0;
        for (int r = 0; r < nrows; ++r) n += selm[r * 64 + lane];
        unsigned base = 0; if (n && !(PROBE_NOATOM && cnt_shift)) base = __hip_atomic_fetch_add(cnt + 64 * lane, n, __ATOMIC_RELAXED, __HIP_MEMORY_SCOPE_AGENT);
        basem[lane] = base; }
    __syncthreads();
    for (int ri = wave; ri < nrows; ri += 8) { unsigned pos = basem[lane];
        for (int r = 0; r < ri; ++r) pos += selm[r * 64 + lane];
        if (selm[ri * 64 + lane]) { const size_t m = (size_t)(wg + (ri >> 4) * G) * 16 + (ri & 15); const int rk = rkm[ri * 64 + lane];
            LIST[lane * T + pos] = (int)m; WL[lane * T + pos] = wtm[ri * 64 + lane]; SLOT[m * 8 + rk] = ((unsigned)lane << 16) | pos; } }
    __syncthreads();
}
__device__ __forceinline__ void phase_combine_ln2(const Params& p, int l, float* dst, int gw, int NGW, int lane) {
    const float* X1 = (const float*)(p.ws + WS_X1); const bf16* YE = (const bf16*)(p.ws + WS_YEXP); const unsigned* SLOT = (const unsigned*)(p.ws + WS_SLOT);
    const unsigned* cnt = (const unsigned*)(p.ws + WS_CTL) + CW_CNT + l * 4096;
    const float* g2 = p.in[I_LN2G] + (size_t)l * D; const float* b2 = p.in[I_LN2B] + (size_t)l * D;
    const int tiles = ((int)cnt[64 * lane] + 255) >> 8; const float incl = wave_scan_incl((float)tiles);
    const int toff = (int)incl - tiles;
    const int tsh = __builtin_amdgcn_readlane((int)incl, 63);
    for (int m = gw; m < T; m += NGW) {
        v4f v[8]; const v4f* xr = (const v4f*)(X1 + (size_t)m * D) + lane;
#pragma unroll
        for (int j = 0; j < 8; ++j) v[j] = xr[64 * j] * ALPHA;
#pragma unroll
        for (int k = 0; k < 7; ++k) { size_t row;
            if (k == 0) row = (size_t)tsh * 256 + m;
            else { const unsigned s = __builtin_amdgcn_readfirstlane(SLOT[(size_t)m * 8 + (k - 1)]); const int e = (int)(s >> 16); row = (size_t)__builtin_amdgcn_readlane(toff, e) * 256 + (s & 0xffffu); }
            const v2u* yr = (const v2u*)(YE + row * D) + lane;
#pragma unroll
            for (int j = 0; j < 8; ++j) { const v2u y = yr[64 * j]; v[j].x += bflo(y.x); v[j].y += bfhi(y.x); v[j].z += bflo(y.y); v[j].w += bfhi(y.y); } }
        float s = 0.f;
#pragma unroll
        for (int j = 0; j < 8; ++j) s += (v[j].x + v[j].y) + (v[j].z + v[j].w);
        const float mean = wave_sum(s) * (1.f / D); float s2 = 0.f;
#pragma unroll
        for (int j = 0; j < 8; ++j) { v[j] = v[j] - mean; s2 += (v[j].x * v[j].x + v[j].y * v[j].y) + (v[j].z * v[j].z + v[j].w * v[j].w); }
        const float rstd = rsqrtf(wave_sum(s2) * (1.f / D) + LN_EPS);
        v4f* xo = (v4f*)(dst + (size_t)m * D) + lane;
#pragma unroll
        for (int j = 0; j < 8; ++j) { const v4f gg = ((const v4f*)g2)[lane + 64 * j], bb = ((const v4f*)b2)[lane + 64 * j]; xo[64 * j] = v[j] * rstd * gg + bb; }
    }
}

constexpr int NPH = 11;
template <class S> struct DupOrder {
    S s; int n;
    __device__ __forceinline__ bool next(int i, Unit& u) const { return s.next(i >= n ? i - n : i, u); }
    __device__ __forceinline__ int row_token(int i, int r) const { return s.row_token(i >= n ? i - n : i, r); }
    __device__ __forceinline__ void a_ready(const Unit& u) const { s.a_ready(u); }
    __device__ __forceinline__ void done(const Unit& u) const { s.done(u); }
};
template <class S> __device__ __forceinline__ int count_units(const S& s) { Unit u; int n = 0; while (n < 64 && s.next(n, u)) ++n; return n; }
#define ORDER_T(k, T) typename std::conditional<PROBE_DUP == (k), DupOrder<T>, T>::type
template <class S> __device__ __forceinline__ DupOrder<S> make_order(const S& s, std::true_type) { DupOrder<S> d{s, count_units(s)}; d.n = count_units(s); return d; }
template <class S> __device__ __forceinline__ S make_order(const S& s, std::false_type) { return s; }
#define MAKE_ORDER(k, s) make_order(s, std::integral_constant<bool, PROBE_DUP == (k)>())
template <int l>
__device__ __forceinline__ void run_layer(const Params& p, LAS unsigned char* lds, const XcdBarrier& bar, int tid, int lane, int wave, int G, int wg, int gw, int NGW) {
    unsigned char* ws = p.ws;
    {
        const float* xin = (l == 0) ? p.in[I_X] : (const float*)(ws + WS_XCUR);
        float* xout = (l == NL - 1) ? p.out : (float*)(ws + WS_XCUR);
#ifndef PROBE_DUP
#define PROBE_DUP (-1)
#endif
#define IS_GEMM_PH(k) ((k) == 1 || (k) == 5 || (k) == 6 || (k) == 8 || (k) == 9)
#define REP(k) _Pragma("nounroll") for (int _r = 0; _r < ((PROBE_DUP == (k) && !IS_GEMM_PH(k)) ? 2 + (p.ph_lo >> 20) : 1); ++_r)
#ifndef PH_MASK
#define PH_MASK 0x7ff
#endif
#define RUN(k) (((PH_MASK >> (k)) & 1) && p.ph_lo <= l * NPH + (k) && l * NPH + (k) < p.ph_hi)
#define SEAM(k) do { if (l * NPH + (k) + 1 < p.ph_hi) xcd_barrier(bar); } while (0)
        if (RUN(0)) { REP(0) { phase_convert<0>(p, l, lds, gw, NGW, wave, lane);
#if defined(PROBE_CONV0)
            phase_convert<1>(p, l, lds, gw, NGW, wave, lane);
#endif
 phase_xprep(p, l, xin, lds, gw, NGW, tid, lane); } SEAM(0); }
        if (RUN(1)) { REP(1) { pg8::Gemm g{(const bf16*)(ws + WS_XB), (const bf16*)(ws + WS_WIN), T, ZC, D / 2, D / 2, D / 2}; pg8::StaticOrder S; S.init(T, ZC, G, wg);
            pg8::EpiBf16<0> E{(bf16*)(ws + WS_Z), ZC, nullptr, 0, 0, 1.f / 64.f};
            auto S2 = MAKE_ORDER(1, S); pg8::gemm_phase<pg8::EpiBf16<0>, ORDER_T(1, pg8::StaticOrder), true, true, true>(lds, g, S2, E); } SEAM(1); }
        if (RUN(2)) { REP(2) { for (int it = wg; it < 1536; it += G) { if (it < 512) gdn_pre_item(p, l, lds, it, tid, wave, lane); else if (it < 1024) ml_pre_item(p, l, lds, it - 512, tid, wave, lane); else vt_item(p, lds, it - 1024, tid); } } SEAM(2); }
        if (RUN(3)) { REP(3) { phase_mixers(p, l, lds, wg, G, tid, wave, lane, bar); } SEAM(3); }
        if (RUN(4)) { REP(4) { phase_post(p, l, gw, NGW, lane); } SEAM(4); }
        if (RUN(5)) { REP(5) { pg8::Gemm g{(const bf16*)(ws + WS_BR), (const bf16*)(ws + WS_WBR), T, D, BRW, BRW, BRW}; pg8::StaticOrder S; S.init(T, D, G, wg);
            EpiMergeH E{(const bf16*)(ws + WS_Z), (bf16*)(ws + WS_MSUM)};
            auto S2 = MAKE_ORDER(5, S); pg8::gemm_phase<EpiMergeH, ORDER_T(5, pg8::StaticOrder), true, true>(lds, g, S2, E); } SEAM(5); }
        if (RUN(6)) { REP(6) { pg8::Gemm g{(const bf16*)(ws + WS_MSUM), (const bf16*)(ws + WS_WOUT), T, D, D / 2, D / 2, D / 2}; pg8::StaticOrder S; S.init(T, D, G, wg);
            EpiResid E{xin, (float*)(ws + WS_Y), 1.f / 64.f};
            auto S2 = MAKE_ORDER(6, S); pg8::gemm_phase<EpiResid, ORDER_T(6, pg8::StaticOrder), true, true, true>(lds, g, S2, E); } SEAM(6); }
        if (RUN(7)) { REP(7) { phase_ln1_router(p, l, lds, wg, G, wave, lane, (PROBE_DUP == 7 && _r == 0) ? 16384 : 0); } SEAM(7); }
        if (RUN(8)) { REP(8) { const unsigned* cnt = (const unsigned*)(ws + WS_CTL) + CW_CNT + l * 4096; MoeTab M(lds); moe_tables(M, cnt, tid, lane, wave);
            UpOrder S{M, 0}; S.n = up_order_build(M, (const int*)(ws + WS_LIST), (const float*)(ws + WS_WL), wg, G, tid);
            constexpr int KU = MOE_UP_FP8 ? D / 2 : D;
            pg8::Gemm g{(const bf16*)(ws + WS_X1B), (const bf16*)(ws + WS_WUP), T, NEX * 1024, KU, KU, KU};
            EpiGluSparse E{(LAS const float*)M.wt, (bf16*)(ws + WS_HB)};
            auto S2 = MAKE_ORDER(8, S); pg8::gemm_phase_gather<EpiGluSparse, ORDER_T(8, UpOrder), MOE_UP_FP8 != 0>(lds, g, S2, E); } SEAM(8); }
        if (RUN(9)) { REP(9) { const unsigned* cnt = (const unsigned*)(ws + WS_CTL) + CW_CNT + l * 4096; MoeTab M(lds); moe_tables(M, cnt, tid, lane, wave);
            DownOrder S{M, G, wg, 8 * M.t[65]};
            pg8::Gemm g{(const bf16*)(ws + WS_HB), (const bf16*)(ws + WS_WDN), HROWS, NEX * D, ED, ED, ED};
            EpiYexp E{(bf16*)(ws + WS_YEXP)};
            auto S2 = MAKE_ORDER(9, S); pg8::gemm_phase<EpiYexp, ORDER_T(9, DownOrder), true, true>(lds, g, S2, E); } SEAM(9); }
        if (RUN(10)) { REP(10) { phase_combine_ln2(p, l, xout, gw, NGW, lane); } SEAM(10); }
#undef RUN
#undef SEAM
    }
}
__global__ void __launch_bounds__(512, 2) fwd_kernel(Params p) {
    extern __shared__ __attribute__((aligned(16))) unsigned char lds_raw[];
    LAS unsigned char* lds = (LAS unsigned char*)lds_raw;
    const int tid = threadIdx.x, lane = tid & 63, wave = __builtin_amdgcn_readfirstlane(tid >> 6);
    const int G = gridDim.x, wg = blockIdx.x, gw = wg * 8 + wave, NGW = G * 8;
    volatile LAS unsigned* MISC = (volatile LAS unsigned*)(lds + MISC_OFF);
    if (tid < 32) MISC[tid] = 0u;
    __syncthreads();
    unsigned* ctl = (unsigned*)(p.ws + WS_CTL);
    const bool multi = (p.ph_hi - p.ph_lo) > 1;
    XcdBarrier bar; bar.bar = ctl + CW_BAR; bar.x = 0; bar.st = nullptr;
    if (multi) bar = xcd_barrier_post(ctl + CW_BAR, MISC + 8);
    run_layer<0>(p, lds, bar, tid, lane, wave, G, wg, gw, NGW);
    run_layer<1>(p, lds, bar, tid, lane, wave, G, wg, gw, NGW);
}

#ifndef MK_MULTI_LAUNCH
#define MK_MULTI_LAUNCH 0
#endif
extern "C" void kernel_launch(void* const* d_in, const int* in_sizes, int n_in, void* d_out, int out_size, void* d_ws, size_t ws_size, hipStream_t stream) {
    static int grid = 0;
    if (grid == 0) {
        if (n_in != 27 || out_size != T * D || ws_size < WS_END) { fprintf(stderr, "kernel_launch: unexpected shapes (n_in %d out %d ws %zu need %zu)\n", n_in, out_size, ws_size, (size_t)WS_END); grid = -1; return; }
        int dev = 0, cus = 0, per_cu = 0;
        if (hipGetDevice(&dev) != hipSuccess || hipDeviceGetAttribute(&cus, hipDeviceAttributeMultiprocessorCount, dev) != hipSuccess) { grid = -1; return; }
        if (hipFuncSetAttribute((const void*)fwd_kernel, hipFuncAttributeMaxDynamicSharedMemorySize, LDS_BYTES) != hipSuccess) { fprintf(stderr, "kernel_launch: hipFuncSetAttribute failed\n"); grid = -1; return; }
        if (hipOccupancyMaxActiveBlocksPerMultiprocessor(&per_cu, (const void*)fwd_kernel, 512, LDS_BYTES) != hipSuccess || per_cu < 1) { fprintf(stderr, "kernel_launch: occupancy query says %d\n", per_cu); }
        (void)hipGetLastError();
        grid = cus;
    }
    if (grid < 0) return;
    (void)hipMemsetAsync((char*)d_ws + WS_CTL, 0, CTL_ZERO_BYTES, stream);
    Params p{};
    for (int i = 0; i < 27; ++i) p.in[i] = (const float*)d_in[i];
    p.out = (float*)d_out; p.ws = (unsigned char*)d_ws;
#if MK_MULTI_LAUNCH
    for (int ph = 0; ph < NL * NPH; ++ph) { p.ph_lo = ph; p.ph_hi = ph + 1; hipLaunchKernelGGL(fwd_kernel, dim3(grid), dim3(512), LDS_BYTES, stream, p); }
#else
    p.ph_lo = 0; p.ph_hi = NL * NPH; hipLaunchKernelGGL(fwd_kernel, dim3(grid), dim3(512), LDS_BYTES, stream, p);
#endif
}
```

```cpp
#include <hip/hip_runtime.h>
#include <cstdio>
#include <cstdint>
#include <type_traits>
namespace pg8 {
#define PG8_LAS __attribute__((address_space(3)))
typedef unsigned short bf16_t;
typedef short bf16x8 __attribute__((ext_vector_type(8)));
typedef float f32x4 __attribute__((ext_vector_type(4)));
typedef unsigned u32x4 __attribute__((ext_vector_type(4)));
constexpr int BM = 256, BK = 64, HALF = 128, HTB = HALF * BK * 2  , STAGE_BYTES = 8 * HTB, NXCD = 8, WGM = 8;

__host__ __device__ __forceinline__ int lds_byte(int r, int c) { const int st = (r >> 4) * 2 + (c >> 5), rr = r & 15, cc = c & 31, ob = rr * 64 + cc * 2; return st * 1024 + (ob ^ (((ob >> 9) & 1) << 5)); }
__host__ __device__ __forceinline__ void stage_rc(int b, int& R, int& C) { const int st = b / 1024, sb = b % 1024, swz = sb ^ (((sb >> 9) & 1) << 5); R = (st >> 1) * 16 + swz / 64; C = (st & 1) * 32 + (swz % 64) / 2; }
__host__ __device__ __forceinline__ int perm32(int rho) { const int n = rho >> 4, i = rho & 15; return 8 * (i >> 2) + 4 * n + (i & 3); }

struct Unit { int pm, pn, aux; };
struct Gemm { const bf16_t* A; const bf16_t* Bt; int M, N, K, lda, ldb; };

struct StaticOrder {
    int nM, nN, nwg, G, c;
    __host__ __device__ void init(int M, int N, int G_, int c_) { nM = M / BM; nN = N / BM; nwg = nM * nN; G = G_; c = c_; }
    __host__ __device__ bool next(int i, Unit& u) const {
        const long L = (long)i * G + c; if (L >= nwg) return false;
        int wgid = (int)L; { const int q = nwg / NXCD, r = nwg % NXCD, xcd = wgid % NXCD, off = wgid / NXCD; wgid = (xcd < r ? xcd * (q + 1) : r * (q + 1) + (xcd - r) * q) + off; }
        const int nig = WGM * nN, gid = wgid / nig, fm = gid * WGM, gsz = (nM - fm) < WGM ? (nM - fm) : WGM;
        u.pm = fm + ((wgid % nig) % gsz); u.pn = (wgid % nig) / gsz; return true;
    }
    __device__ __forceinline__ void a_ready(const Unit&) const {}
    __device__ __forceinline__ void done(const Unit&) const {}
};

__device__ __forceinline__ unsigned cvt_pk_bf16(float lo, float hi) { unsigned r; asm volatile("v_cvt_pk_bf16_f32 %0, %1, %2" : "=v"(r) : "v"(lo), "v"(hi)); return r; }
typedef float f32x2 __attribute__((ext_vector_type(2)));
__device__ __forceinline__ f32x2 gelu_pk(f32x2 v) {
    const f32x2 av = __builtin_elementwise_abs(v), d = av * 0.2316418882f + 1.0f;
    f32x2 t; t.x = __builtin_amdgcn_rcpf(d.x); t.y = __builtin_amdgcn_rcpf(d.y);
    f32x2 q = t * 0.5307027145f + (-0.7265760135f); q = q * t + 0.7107068705f; q = q * t + (-0.142248368f); q = q * t + 0.127414796f; q = q * t;
    const f32x2 s = (v * v) * (-0.72134752044f);
    f32x2 e; e.x = __builtin_amdgcn_exp2f(s.x); e.y = __builtin_amdgcn_exp2f(s.y);
    const f32x2 m = v * (q * e), r = v - m;
    f32x2 o; o.x = v.x < 0.f ? m.x : r.x; o.y = v.y < 0.f ? m.y : r.y; return o;
}

template <int ACT  > struct EpiBf16 {
    static constexpr bool PERM = true, AFTER_DRAIN = false; static constexpr int MID = 0; static_assert(ACT == 0 || ACT == 1, "EpiBf16: ACT is 0 (none) or 1 (gelu_pk)");
    bf16_t* O; int ldc; const float* bias; int split_cols; size_t split_stride; float scale0;
    __device__ __forceinline__ void operator()(const f32x4 (&acc)[2][2][4][2], const Unit& u, int wr, int wc, int fr, int fq) const {
        const int row0 = u.pm * BM + wr * 64 + fr; int colt = u.pn * BM; bf16_t* base = O;
        float sc = scale0; if (split_cols) { const int t = colt / split_cols; base += (size_t)t * split_stride; colt -= t * split_cols; if (t != 0) sc = 1.f; }
        const int col0 = colt + wc * 32 + 8 * fq, bcol0 = u.pn * BM + wc * 32 + 8 * fq;
        f32x4 bv[2][2];
#pragma unroll
        for (int bj = 0; bj < 2; ++bj)
#pragma unroll
            for (int n = 0; n < 2; ++n) bv[bj][n] = bias ? *(const f32x4*)(bias + bcol0 + bj * HALF + 4 * n) : (f32x4){0.f, 0.f, 0.f, 0.f};
#pragma unroll
        for (int ai = 0; ai < 2; ++ai)
#pragma unroll
            for (int m = 0; m < 4; ++m) { bf16_t* rowp = base + (size_t)(row0 + ai * HALF + m * 16) * ldc + col0;
#pragma unroll
                for (int bj = 0; bj < 2; ++bj) { f32x4 v0 = acc[ai][bj][m][0] + bv[bj][0], v1 = acc[ai][bj][m][1] + bv[bj][1];
                    if (ACT == 1) { f32x2 a = gelu_pk((f32x2){v0[0], v0[1]}), b = gelu_pk((f32x2){v0[2], v0[3]}), c = gelu_pk((f32x2){v1[0], v1[1]}), d = gelu_pk((f32x2){v1[2], v1[3]});
                        v0 = (f32x4){a.x, a.y, b.x, b.y}; v1 = (f32x4){c.x, c.y, d.x, d.y}; }
                    v0 = v0 * sc; v1 = v1 * sc; u32x4 w; w.x = cvt_pk_bf16(v0[0], v0[1]); w.y = cvt_pk_bf16(v0[2], v0[3]); w.z = cvt_pk_bf16(v1[0], v1[1]); w.w = cvt_pk_bf16(v1[2], v1[3]);
                    *(u32x4*)(rowp + bj * HALF) = w; } }
    }
};

typedef int i32x8 __attribute__((ext_vector_type(8)));
__device__ __forceinline__ i32x8 cat8(const bf16x8 a, const bf16x8 b) { typedef int i32x4 __attribute__((ext_vector_type(4))); const i32x4 x = __builtin_bit_cast(i32x4, a), y = __builtin_bit_cast(i32x4, b); return (i32x8){x[0], x[1], x[2], x[3], y[0], y[1], y[2], y[3]}; }
__device__ __forceinline__ bf16x8 lo8(const i32x8 v) { typedef int i32x4 __attribute__((ext_vector_type(4))); return __builtin_bit_cast(bf16x8, __builtin_shufflevector(v, v, 0, 1, 2, 3)); }
__device__ __forceinline__ bf16x8 hi8(const i32x8 v) { typedef int i32x4 __attribute__((ext_vector_type(4))); return __builtin_bit_cast(bf16x8, __builtin_shufflevector(v, v, 4, 5, 6, 7)); }
template <class Epi, class Sched, bool ALIGN_EPI = false, bool SP2 = false, bool FP8 = false>
__device__ __forceinline__ void gemm_phase(PG8_LAS unsigned char* lds, const Gemm g, const Sched& S, const Epi& E) {
    const int tid = threadIdx.x, wid = __builtin_amdgcn_readfirstlane(tid >> 6), lane = tid & 63, wr = wid >> 2, wc = wid & 3, fr = lane & 15, fq = lane >> 4;
    const int K = g.K, nt = K / BK;
    unsigned voffA[2], voffB[2];
#pragma unroll
    for (int i = 0; i < 2; ++i) { int R, C; stage_rc(tid * 16 + i * 8192, R, C); const int Rb = Epi::PERM ? ((R & ~31) + perm32(R & 31)) : R;
        voffA[i] = (unsigned)(R * g.lda + C) * 2u; voffB[i] = (unsigned)(Rb * g.ldb + C) * 2u; }
    const size_t kstep = (size_t)(BK * 2);
    const size_t hstepA = (size_t)HALF * g.lda * 2, hstepB = (size_t)HALF * g.ldb * 2;
    const size_t tstepA = 2 * hstepA, tstepB = 2 * hstepB;
    const unsigned ldsw = (unsigned)wid * 1024u;
    const int aoff = lds_byte(wr * 64 + fr, fq * 8), boff = lds_byte(wc * 32 + fr, fq * 8);
#define PG8_SA(b, h) (((b) * 2 + (h)) * HTB)
#define PG8_SB(b, h) ((4 + (b) * 2 + (h)) * HTB)
#define PG8_STAGE(bufoff, gbase, voff) do { _Pragma("unroll") for (int _i = 0; _i < 2; ++_i) \
        __builtin_amdgcn_global_load_lds((const unsigned*)((const char*)(gbase) + (voff)[_i]), (PG8_LAS unsigned*)(lds + (bufoff) + ldsw + _i * 8192), 16, 0, 0); } while (0)
#define PG8_LDA(dst, b, h) do { _Pragma("unroll") for (int m = 0; m < 4; ++m) { if constexpr (FP8) dst##8[m] = cat8(*(const PG8_LAS bf16x8*)(lds + PG8_SA(b, h) + aoff + m * 2048), *(const PG8_LAS bf16x8*)(lds + PG8_SA(b, h) + aoff + m * 2048 + 1024)); \
        else { _Pragma("unroll") for (int k = 0; k < 2; ++k) dst[m][k] = *(const PG8_LAS bf16x8*)(lds + PG8_SA(b, h) + aoff + m * 2048 + k * 1024); } } } while (0)
#define PG8_LDB(dst, b, h) do { _Pragma("unroll") for (int n = 0; n < 2; ++n) { if constexpr (FP8) dst##8[n] = cat8(*(const PG8_LAS bf16x8*)(lds + PG8_SB(b, h) + boff + n * 2048), *(const PG8_LAS bf16x8*)(lds + PG8_SB(b, h) + boff + n * 2048 + 1024)); \
        else { _Pragma("unroll") for (int k = 0; k < 2; ++k) dst[n][k] = *(const PG8_LAS bf16x8*)(lds + PG8_SB(b, h) + boff + n * 2048 + k * 1024); } } } while (0)
#define PG8_MMA(ai, bj, At, Bt) do { __builtin_amdgcn_s_setprio(1); _Pragma("unroll") for (int m = 0; m < 4; ++m) _Pragma("unroll") for (int n = 0; n < 2; ++n) { \
        if constexpr (FP8) asm volatile("v_mfma_scale_f32_16x16x128_f8f6f4 %0, %1, %2, %0, %3, %3 op_sel_hi:[0,0,0]" : "+v"(acc[ai][bj][m][n]) : "v"(Bt##8[n]), "v"(At##8[m]), "v"(fp8_unit_scale)); \
        else { _Pragma("unroll") for (int k = 0; k < 2; ++k) acc[ai][bj][m][n] = __builtin_amdgcn_mfma_f32_16x16x32_bf16(Bt[n][k], At[m][k], acc[ai][bj][m][n], 0, 0, 0); } } __builtin_amdgcn_s_setprio(0); } while (0)
#define PG8_WAIT_V(n) asm volatile("s_waitcnt vmcnt(" #n ")" ::: "memory")
#define PG8_WAIT_L(n) asm volatile("s_waitcnt lgkmcnt(" #n ")" ::: "memory")
#define PG8_BAR __builtin_amdgcn_s_barrier()
#define PG8_SCHED __builtin_amdgcn_sched_barrier(0)
    Unit cur, nxt; int ui = 0;
    if (!S.next(0, cur)) return;
    f32x4 acc[2][2][4][2];
#pragma unroll
    for (int a = 0; a < 2; ++a)
#pragma unroll
        for (int b = 0; b < 2; ++b)
#pragma unroll
            for (int m = 0; m < 4; ++m)
#pragma unroll
                for (int n = 0; n < 2; ++n) acc[a][b][m][n] = (f32x4){0.f, 0.f, 0.f, 0.f};
    int fp8_unit_scale = 0x7F7F7F7F; asm volatile("" : "+v"(fp8_unit_scale));
    bf16x8 At[4][2], B0[2][2], B1[2][2];
    i32x8 At8[4], B08[2], B18[2];
    const char* cA = (const char*)g.A + (size_t)cur.pm * tstepA; const char* cB = (const char*)g.Bt + (size_t)cur.pn * tstepB;
    S.a_ready(cur);
    if constexpr (SP2) {
        PG8_STAGE(PG8_SB(0, 0), cB, voffB); PG8_STAGE(PG8_SB(0, 1), cB + hstepB, voffB); PG8_STAGE(PG8_SA(0, 0), cA, voffA); PG8_STAGE(PG8_SA(0, 1), cA + hstepA, voffA);
        if (wr == 1) PG8_BAR;
        PG8_WAIT_V(2); PG8_BAR;
        PG8_STAGE(PG8_SB(1, 0), cB + kstep, voffB); PG8_STAGE(PG8_SA(1, 0), cA + kstep, voffA); PG8_STAGE(PG8_SB(1, 1), cB + hstepB + kstep, voffB);
        PG8_WAIT_V(6); PG8_BAR;
    } else {
        PG8_STAGE(PG8_SB(0, 0), cB, voffB); PG8_STAGE(PG8_SA(0, 0), cA, voffA); PG8_STAGE(PG8_SB(0, 1), cB + hstepB, voffB); PG8_STAGE(PG8_SA(0, 1), cA + hstepA, voffA);
        if (wr == 1) PG8_BAR;
        PG8_WAIT_V(4); PG8_BAR;
        PG8_STAGE(PG8_SB(1, 0), cB + kstep, voffB); PG8_STAGE(PG8_SA(1, 0), cA + kstep, voffA); PG8_STAGE(PG8_SB(1, 1), cB + hstepB + kstep, voffB);
        PG8_WAIT_V(6); PG8_BAR;
    }
    for (;;) {
        const bool has_next = S.next(ui + 1, nxt);
        const char* nA = has_next ? (const char*)g.A + (size_t)nxt.pm * tstepA : cA; const char* nB = has_next ? (const char*)g.Bt + (size_t)nxt.pn * tstepB : cB;
        for (int t = 0; t < nt; t += 2) {
            const bool last = (t == nt - 2);
            const char* a1 = cA + (size_t)(t + 1) * kstep;
            const char* a2 = last ? nA : cA + (size_t)(t + 2) * kstep; const char* b2 = last ? nB : cB + (size_t)(t + 2) * kstep;
            const char* a3 = a2 + kstep; const char* b3 = b2 + kstep;
            if (last && has_next) S.a_ready(nxt);
            if constexpr (SP2) {
            if constexpr (Epi::MID > 0) { if (t != 0 && (t % Epi::MID) == 0) { PG8_SCHED; E.mid(acc, cur, t / Epi::MID, wr, wc, fr, fq); PG8_SCHED; } }
            PG8_LDB(B0, 0, 0); PG8_LDB(B1, 0, 1); PG8_SCHED; PG8_LDA(At, 0, 0); PG8_STAGE(PG8_SA(1, 1), a1 + hstepA, voffA);
            PG8_WAIT_V(8); PG8_WAIT_L(0); PG8_BAR; PG8_MMA(0, 0, At, B0); PG8_MMA(0, 1, At, B1); PG8_BAR; PG8_SCHED;
            PG8_LDA(At, 0, 1); PG8_STAGE(PG8_SB(0, 0), b2, voffB); PG8_STAGE(PG8_SB(0, 1), b2 + hstepB, voffB); PG8_STAGE(PG8_SA(0, 0), a2, voffA);
            PG8_WAIT_V(8); PG8_WAIT_L(0); PG8_BAR; PG8_MMA(1, 0, At, B0); PG8_MMA(1, 1, At, B1); PG8_BAR; PG8_SCHED;
            PG8_LDB(B0, 1, 0); PG8_LDB(B1, 1, 1); PG8_SCHED; PG8_LDA(At, 1, 0); PG8_STAGE(PG8_SA(0, 1), a2 + hstepA, voffA);
            PG8_WAIT_V(8); PG8_WAIT_L(0); PG8_BAR; PG8_MMA(0, 0, At, B0); PG8_MMA(0, 1, At, B1); PG8_BAR; PG8_SCHED;
            PG8_LDA(At, 1, 1); PG8_STAGE(PG8_SB(1, 0), b3, voffB); PG8_STAGE(PG8_SB(1, 1), b3 + hstepB, voffB); PG8_STAGE(PG8_SA(1, 0), a3, voffA);
            PG8_WAIT_V(8); PG8_WAIT_L(0); PG8_BAR; PG8_MMA(1, 0, At, B0); PG8_MMA(1, 1, At, B1); PG8_BAR; PG8_SCHED;
            } else {
            PG8_LDB(B0, 0, 0); PG8_SCHED; PG8_LDA(At, 0, 0); PG8_STAGE(PG8_SA(1, 1), a1 + hstepA, voffA);
            PG8_WAIT_L(8); PG8_BAR; PG8_WAIT_L(0); PG8_MMA(0, 0, At, B0); PG8_BAR; PG8_SCHED;
            PG8_LDB(B1, 0, 1); PG8_STAGE(PG8_SB(0, 0), b2, voffB);
            PG8_BAR; PG8_WAIT_L(0); PG8_MMA(0, 1, At, B1); PG8_BAR;
            PG8_LDA(At, 0, 1); PG8_STAGE(PG8_SA(0, 0), a2, voffA);
            PG8_BAR; PG8_WAIT_L(0); PG8_MMA(1, 0, At, B0); PG8_BAR; PG8_SCHED;
            PG8_STAGE(PG8_SB(0, 1), b2 + hstepB, voffB);
            PG8_WAIT_V(6); PG8_BAR; PG8_MMA(1, 1, At, B1); PG8_BAR;
            PG8_LDB(B0, 1, 0); PG8_SCHED; PG8_LDA(At, 1, 0); PG8_STAGE(PG8_SA(0, 1), a2 + hstepA, voffA);
            PG8_WAIT_L(8); PG8_BAR; PG8_WAIT_L(0); PG8_MMA(0, 0, At, B0); PG8_BAR; PG8_SCHED;
            PG8_LDB(B1, 1, 1); PG8_STAGE(PG8_SB(1, 0), b3, voffB);
            PG8_BAR; PG8_WAIT_L(0); PG8_MMA(0, 1, At, B1); PG8_BAR;
            PG8_LDA(At, 1, 1); PG8_STAGE(PG8_SA(1, 0), a3, voffA);
            PG8_BAR; PG8_WAIT_L(0); PG8_MMA(1, 0, At, B0); PG8_BAR; PG8_SCHED;
            PG8_STAGE(PG8_SB(1, 1), b3 + hstepB, voffB);
            PG8_WAIT_V(6); PG8_BAR; PG8_MMA(1, 1, At, B1); PG8_BAR;
            }
        }
        if constexpr (ALIGN_EPI) { if (wr == 0) PG8_BAR; }
        if constexpr (FP8) asm volatile("s_nop 7\n\ts_nop 7" ::: "memory");
        if constexpr (!Epi::AFTER_DRAIN) { E(acc, cur, wr, wc, fr, fq); S.done(cur); }
        if (!has_next) break;
#pragma unroll
        for (int a = 0; a < 2; ++a)
#pragma unroll
            for (int b = 0; b < 2; ++b)
#pragma unroll
                for (int m = 0; m < 4; ++m)
#pragma unroll
                    for (int n = 0; n < 2; ++n) acc[a][b][m][n] = (f32x4){0.f, 0.f, 0.f, 0.f};
        cur = nxt; cA = nA; cB = nB; ++ui;
        if constexpr (ALIGN_EPI) { if (wr == 1) PG8_BAR; }
    }
    PG8_WAIT_V(0);
    if constexpr (!ALIGN_EPI) { if (wr == 0) PG8_BAR; }
    PG8_BAR;
    if constexpr (Epi::AFTER_DRAIN) { E.fused(acc, cur, wr, wc, fr, fq, lds, wid, lane); S.done(cur); }
#undef PG8_SA
#undef PG8_SB
#undef PG8_STAGE
#undef PG8_LDA
#undef PG8_LDB
#undef PG8_MMA
#undef PG8_WAIT_V
#undef PG8_WAIT_L
#undef PG8_BAR
#undef PG8_SCHED
}
template <class Epi, class Sched, bool FP8 = false>
__device__ __forceinline__ void gemm_phase_gather(PG8_LAS unsigned char* lds, const Gemm g, const Sched& S, const Epi& E) {
    const int tid = threadIdx.x, wid = __builtin_amdgcn_readfirstlane(tid >> 6), lane = tid & 63, wr = wid >> 2, wc = wid & 3, fr = lane & 15, fq = lane >> 4;
    const int K = g.K, nt = K / BK;
    unsigned voffB[2]; int RA[2], CA[2];
#pragma unroll
    for (int i = 0; i < 2; ++i) { int R, C; stage_rc(tid * 16 + i * 8192, R, C); const int Rb = Epi::PERM ? ((R & ~31) + perm32(R & 31)) : R;
        RA[i] = R; CA[i] = C; voffB[i] = (unsigned)(Rb * g.ldb + C) * 2u; }
    const size_t kstep = (size_t)(BK * 2);
    const size_t hstepB = (size_t)HALF * g.ldb * 2, tstepB = 2 * hstepB;
    const unsigned ldsw = (unsigned)wid * 1024u;
    const int aoff = lds_byte(wr * 64 + fr, fq * 8), boff = lds_byte(wc * 32 + fr, fq * 8);
#define PG8_SA(b, h) (((b) * 2 + (h)) * HTB)
#define PG8_SB(b, h) ((4 + (b) * 2 + (h)) * HTB)
#define PG8_STAGE(bufoff, gbase, voff) do { _Pragma("unroll") for (int _i = 0; _i < 2; ++_i) \
        __builtin_amdgcn_global_load_lds((const unsigned*)((const char*)(gbase) + (voff)[_i]), (PG8_LAS unsigned*)(lds + (bufoff) + ldsw + _i * 8192), 16, 0, 0); } while (0)
#define PG8_LDA(dst, b, h) do { _Pragma("unroll") for (int m = 0; m < 4; ++m) { if constexpr (FP8) dst##8[m] = cat8(*(const PG8_LAS bf16x8*)(lds + PG8_SA(b, h) + aoff + m * 2048), *(const PG8_LAS bf16x8*)(lds + PG8_SA(b, h) + aoff + m * 2048 + 1024)); \
        else { _Pragma("unroll") for (int k = 0; k < 2; ++k) dst[m][k] = *(const PG8_LAS bf16x8*)(lds + PG8_SA(b, h) + aoff + m * 2048 + k * 1024); } } } while (0)
#define PG8_LDB(dst, b, h) do { _Pragma("unroll") for (int n = 0; n < 2; ++n) { if constexpr (FP8) dst##8[n] = cat8(*(const PG8_LAS bf16x8*)(lds + PG8_SB(b, h) + boff + n * 2048), *(const PG8_LAS bf16x8*)(lds + PG8_SB(b, h) + boff + n * 2048 + 1024)); \
        else { _Pragma("unroll") for (int k = 0; k < 2; ++k) dst[n][k] = *(const PG8_LAS bf16x8*)(lds + PG8_SB(b, h) + boff + n * 2048 + k * 1024); } } } while (0)
#define PG8_MMA(ai, bj, At, Bt) do { __builtin_amdgcn_s_setprio(1); _Pragma("unroll") for (int m = 0; m < 4; ++m) _Pragma("unroll") for (int n = 0; n < 2; ++n) { \
        if constexpr (FP8) asm volatile("v_mfma_scale_f32_16x16x128_f8f6f4 %0, %1, %2, %0, %3, %3 op_sel_hi:[0,0,0]" : "+v"(acc[ai][bj][m][n]) : "v"(Bt##8[n]), "v"(At##8[m]), "v"(fp8_unit_scale)); \
        else { _Pragma("unroll") for (int k = 0; k < 2; ++k) acc[ai][bj][m][n] = __builtin_amdgcn_mfma_f32_16x16x32_bf16(Bt[n][k], At[m][k], acc[ai][bj][m][n], 0, 0, 0); } } __builtin_amdgcn_s_setprio(0); } while (0)
#define PG8_WAIT_V(n) asm volatile("s_waitcnt vmcnt(" #n ")" ::: "memory")
#define PG8_WAIT_L(n) asm volatile("s_waitcnt lgkmcnt(" #n ")" ::: "memory")
#define PG8_BAR __builtin_amdgcn_s_barrier()
#define PG8_SCHED __builtin_amdgcn_sched_barrier(0)
#define PG8_ROWS(dst, ui_) do { _Pragma("unroll") for (int _h = 0; _h < 2; ++_h) _Pragma("unroll") for (int _i = 0; _i < 2; ++_i) \
        dst[_h][_i] = (unsigned)S.row_token((ui_), _h * HALF + RA[_i]) * (unsigned)(g.lda * 2) + (unsigned)(CA[_i] * 2); } while (0)
    Unit cur, nxt; int ui = 0;
    if (!S.next(0, cur)) return;
    f32x4 acc[2][2][4][2];
#pragma unroll
    for (int a = 0; a < 2; ++a)
#pragma unroll
        for (int b = 0; b < 2; ++b)
#pragma unroll
            for (int m = 0; m < 4; ++m)
#pragma unroll
                for (int n = 0; n < 2; ++n) acc[a][b][m][n] = (f32x4){0.f, 0.f, 0.f, 0.f};
    int fp8_unit_scale = 0x7F7F7F7F; asm volatile("" : "+v"(fp8_unit_scale));
    bf16x8 At[4][2], B0[2][2], B1[2][2];
    i32x8 At8[4], B08[2], B18[2];
    unsigned offC[2][2];
    PG8_ROWS(offC, 0);
    const char* gA = (const char*)g.A;
    const char* cB = (const char*)g.Bt + (size_t)cur.pn * tstepB;
    PG8_STAGE(PG8_SB(0, 0), cB, voffB); PG8_STAGE(PG8_SB(0, 1), cB + hstepB, voffB); PG8_STAGE(PG8_SA(0, 0), gA, offC[0]); PG8_STAGE(PG8_SA(0, 1), gA, offC[1]);
    if (wr == 1) PG8_BAR;
    PG8_WAIT_V(2); PG8_BAR;
    PG8_STAGE(PG8_SB(1, 0), cB + kstep, voffB); PG8_STAGE(PG8_SA(1, 0), gA + kstep, offC[0]); PG8_STAGE(PG8_SB(1, 1), cB + hstepB + kstep, voffB);
    PG8_WAIT_V(6); PG8_BAR;
    for (;;) {
        const bool has_next = S.next(ui + 1, nxt);
        const char* nB = has_next ? (const char*)g.Bt + (size_t)nxt.pn * tstepB : cB;
        for (int t = 0; t < nt; t += 2) {
            const bool last = (t == nt - 2);
            const char* a1 = gA + (size_t)(t + 1) * kstep;
            const char* a2 = last ? gA : gA + (size_t)(t + 2) * kstep; const char* b2 = last ? nB : cB + (size_t)(t + 2) * kstep;
            const char* a3 = a2 + kstep; const char* b3 = b2 + kstep;
            PG8_LDB(B0, 0, 0); PG8_LDB(B1, 0, 1); PG8_SCHED; PG8_LDA(At, 0, 0); PG8_STAGE(PG8_SA(1, 1), a1, offC[1]);
            if (last && has_next) { PG8_ROWS(offC, ui + 1); }
            PG8_WAIT_V(8); PG8_WAIT_L(0); PG8_BAR; PG8_MMA(0, 0, At, B0); PG8_MMA(0, 1, At, B1); PG8_BAR; PG8_SCHED;
            PG8_LDA(At, 0, 1); PG8_STAGE(PG8_SB(0, 0), b2, voffB); PG8_STAGE(PG8_SB(0, 1), b2 + hstepB, voffB); PG8_STAGE(PG8_SA(0, 0), a2, offC[0]);
            PG8_WAIT_V(8); PG8_WAIT_L(0); PG8_BAR; PG8_MMA(1, 0, At, B0); PG8_MMA(1, 1, At, B1); PG8_BAR; PG8_SCHED;
            PG8_LDB(B0, 1, 0); PG8_LDB(B1, 1, 1); PG8_SCHED; PG8_LDA(At, 1, 0); PG8_STAGE(PG8_SA(0, 1), a2, offC[1]);
            PG8_WAIT_V(8); PG8_WAIT_L(0); PG8_BAR; PG8_MMA(0, 0, At, B0); PG8_MMA(0, 1, At, B1); PG8_BAR; PG8_SCHED;
            PG8_LDA(At, 1, 1); PG8_STAGE(PG8_SB(1, 0), b3, voffB); PG8_STAGE(PG8_SB(1, 1), b3 + hstepB, voffB); PG8_STAGE(PG8_SA(1, 0), a3, offC[0]);
            PG8_WAIT_V(8); PG8_WAIT_L(0); PG8_BAR; PG8_MMA(1, 0, At, B0); PG8_MMA(1, 1, At, B1); PG8_BAR; PG8_SCHED;
        }
        if (wr == 0) PG8_BAR;
        if constexpr (FP8) asm volatile("s_nop 7\n\ts_nop 7" ::: "memory");
        E(acc, cur, wr, wc, fr, fq); S.done(cur);
        if (!has_next) break;
#pragma unroll
        for (int a = 0; a < 2; ++a)
#pragma unroll
            for (int b = 0; b < 2; ++b)
#pragma unroll
                for (int m = 0; m < 4; ++m)
#pragma unroll
                    for (int n = 0; n < 2; ++n) acc[a][b][m][n] = (f32x4){0.f, 0.f, 0.f, 0.f};
        cur = nxt; cB = nB; ++ui;
        if (wr == 1) PG8_BAR;
    }
    PG8_WAIT_V(0);
    PG8_BAR;
#undef PG8_ROWS
#undef PG8_SA
#undef PG8_SB
#undef PG8_STAGE
#undef PG8_LDA
#undef PG8_LDB
#undef PG8_MMA
#undef PG8_WAIT_V
#undef PG8_WAIT_L
#undef PG8_BAR
#undef PG8_SCHED
}
}

#ifndef MOE_UP_FP8
#define MOE_UP_FP8 1
#endif
#ifndef PROBE_NOATOM
#define PROBE_NOATOM 0
#endif
constexpr int T = 8192, D = 2048, NL = 2, BW = 512, ZC = 14336, INC = 14352;
constexpr int NE = 64, NEX = 65  , ED = 512;
constexpr int BRW = 4 * BW;
constexpr int HK = NEX * ED;
constexpr float ALPHA = 1.41421356237f;
constexpr float LN_EPS = 1e-5f;
constexpr float UPSC = MOE_UP_FP8 ? (1.f / 64.f) : 1.f;
constexpr int ZC_SBQ = 0, ZC_SBK = 512, ZC_SBV = 1024, ZC_GMU = 1536, ZC_GMV = 2048, ZC_GDN = 2560, ZC_GDNG = 4096,
              ZC_MLQ = 4608, ZC_MLK = 4864, ZC_MLV = 5120, ZC_MLO = 5632, ZC_GATE = 6144;

#define GAS __attribute__((address_space(1)))
#define LAS __attribute__((address_space(3)))
typedef unsigned short bf16;
typedef unsigned v4u __attribute__((ext_vector_type(4)));
typedef unsigned v2u __attribute__((ext_vector_type(2)));
typedef float v4f __attribute__((ext_vector_type(4)));
typedef float v2f __attribute__((ext_vector_type(2)));
#define LDS_WAIT() asm volatile("s_waitcnt lgkmcnt(0)" ::: "memory")
#define LDS_BAR() do { asm volatile("s_waitcnt lgkmcnt(0)" ::: "memory"); __builtin_amdgcn_s_barrier(); asm volatile("" ::: "memory"); } while (0)

constexpr size_t MiB = 1u << 20;
constexpr size_t WS_CTL = 0, CTL_ZERO_BYTES = 1 * MiB;
constexpr size_t WS_WIN = 2 * MiB, WS_WBR = 58 * MiB, WS_WOUT = 66 * MiB, WS_WUP = 74 * MiB, WS_WDN = 334 * MiB;
constexpr size_t WS_XB = 464 * MiB, WS_SMALL = 496 * MiB, WS_EG = 497 * MiB, WS_BETA = WS_EG + 256 * 1024, WS_COMB = 498 * MiB;
constexpr size_t WS_Z = 500 * MiB, WS_GQ = 724 * MiB, WS_GK = 740 * MiB, WS_GV = 756 * MiB, WS_GO = 772 * MiB, WS_HO = 788 * MiB;
constexpr size_t WS_BR = 804 * MiB, WS_MTMP = 836 * MiB, WS_MSUM = 900 * MiB, WS_Y = 932 * MiB, WS_X1 = 996 * MiB, WS_X1B = 1060 * MiB;
constexpr size_t WS_XCUR = 1092 * MiB, WS_HB = 1156 * MiB, WS_YEXP = 1236 * MiB, WS_LIST = 1524 * MiB, WS_WL = 1526 * MiB, WS_SLOT = 1528 * MiB, WS_MQ = 1530 * MiB, WS_MS = 1534 * MiB, WS_MK = 1538 * MiB, WS_MV = 1542 * MiB, WS_MFL = 1552 * MiB, WS_HDEN = WS_MFL + 65536, WS_VT = 1553 * MiB, WS_END = 1561 * MiB;
constexpr size_t WS_GU = WS_GQ, WS_GNW = WS_GK, WS_GQG = WS_GK + 8 * MiB, WS_GKT = WS_GV, WS_GAT = WS_GV + 8 * MiB, WS_GDL = WS_GV + 12 * MiB;
constexpr int HROWS = 73728;
static_assert(WS_HB + (size_t)HROWS * ED * 2 <= WS_YEXP && WS_YEXP + (size_t)HROWS * D * 2 <= WS_LIST, "ws map (moe)");
static_assert(WS_WIN + (size_t)ZC * D * 2 <= WS_WBR && WS_WUP + (size_t)NEX * 1024 * D * 2 <= WS_WDN && WS_WDN + (size_t)D * HK * 2 <= WS_XB, "ws map (weights)");
static_assert(WS_Z + (size_t)T * ZC * 2 <= WS_GQ, "ws map (acts)");
constexpr int CW_BAR = 4096, CW_CNT = 16384;
constexpr int TAB_OFF = 131072 + 1024;
constexpr int LDS_BYTES = 163840, MISC_OFF = 131072 + 320;

__device__ __forceinline__ float bflo(unsigned w) { return __uint_as_float(w << 16); }
__device__ __forceinline__ float bfhi(unsigned w) { return __uint_as_float(w & 0xffff0000u); }
__device__ __forceinline__ unsigned f2bf(float f) { unsigned u = __float_as_uint(f); return (u + 0x7fffu + ((u >> 16) & 1u)) >> 16; }
__device__ __forceinline__ unsigned pk2(float lo, float hi) { return f2bf(lo) | (f2bf(hi) << 16); }
template <int CTRL> __device__ __forceinline__ float dpp(float x) { return __builtin_bit_cast(float, __builtin_amdgcn_mov_dpp(__builtin_bit_cast(int, x), CTRL, 0xf, 0xf, true)); }
__device__ __forceinline__ float sum4(float x) { x += dpp<0xB1>(x); x += dpp<0x4E>(x); return x; }
__device__ __forceinline__ float sum8(float x) { x = sum4(x); x += dpp<0x141>(x); return x; }
__device__ __forceinline__ float sum16(float x) { x = sum8(x); x += dpp<0x140>(x); return x; }
__device__ __forceinline__ float wave_sum(float x) { x = sum16(x); x += __shfl_xor(x, 16); x += __shfl_xor(x, 32); return x; }
__device__ __forceinline__ float max8(float x) { x = fmaxf(x, dpp<0xB1>(x)); x = fmaxf(x, dpp<0x4E>(x)); x = fmaxf(x, dpp<0x141>(x)); return x; }
__device__ __forceinline__ float min8(float x) { x = fminf(x, dpp<0xB1>(x)); x = fminf(x, dpp<0x4E>(x)); x = fminf(x, dpp<0x141>(x)); return x; }
__device__ __forceinline__ float wave_scan_incl(float v) {
    v += __builtin_bit_cast(float, __builtin_amdgcn_update_dpp(0, __builtin_bit_cast(int, v), 0x111, 0xf, 0xf, true));
    v += __builtin_bit_cast(float, __builtin_amdgcn_update_dpp(0, __builtin_bit_cast(int, v), 0x112, 0xf, 0xf, true));
    v += __builtin_bit_cast(float, __builtin_amdgcn_update_dpp(0, __builtin_bit_cast(int, v), 0x114, 0xf, 0xf, true));
    v += __builtin_bit_cast(float, __builtin_amdgcn_update_dpp(0, __builtin_bit_cast(int, v), 0x118, 0xf, 0xf, true));
    v += __builtin_bit_cast(float, __builtin_amdgcn_update_dpp(0, __builtin_bit_cast(int, v), 0x142, 0xa, 0xf, false));
    v += __builtin_bit_cast(float, __builtin_amdgcn_update_dpp(0, __builtin_bit_cast(int, v), 0x143, 0xc, 0xf, false));
    return v;
}
__device__ __forceinline__ float sigmoidf_(float x) { return 1.f / (1.f + __expf(-x)); }
__device__ __forceinline__ float siluf_(float x) { return x / (1.f + __expf(-x)); }
__device__ __forceinline__ float softplusf_(float x) { return fmaxf(x, 0.f) + __logf(1.f + __expf(-fabsf(x))); }
__device__ __forceinline__ float gelu_tanh(float x) { const float y = 0.7978845608f * (x + 0.044715f * x * x * x); const float t = 1.f - 2.f / (__expf(2.f * y) + 1.f); return 0.5f * x * (1.f + t); }
__device__ __forceinline__ void unpack8(const v4u r, float (&f)[8]) { f[0] = bflo(r.x); f[1] = bfhi(r.x); f[2] = bflo(r.y); f[3] = bfhi(r.y); f[4] = bflo(r.z); f[5] = bfhi(r.z); f[6] = bflo(r.w); f[7] = bfhi(r.w); }
#define XB_TMO      128
#define XB_XCNT(j)  (256  + 64 * (j))
#define XB_XSUB(j)  (1280 + 64 * (j))
#define XB_XGEN(j)  (2304 + 64 * (j))
#define XB_TOP      3328
#define XB_TOPGEN   3392
#define XCD_BAR_WORDS 3456
#define XB_SPIN_CAP (1u << 18)

__device__ __forceinline__ unsigned xb_ld(unsigned* p)              { return __hip_atomic_load(p, __ATOMIC_RELAXED, __HIP_MEMORY_SCOPE_AGENT); }
__device__ __forceinline__ unsigned xb_add(unsigned* p, unsigned v) { return __hip_atomic_fetch_add(p, v, __ATOMIC_RELAXED, __HIP_MEMORY_SCOPE_AGENT); }
__device__ __forceinline__ unsigned xb_xcc_id() { return (unsigned)__builtin_amdgcn_s_getreg((3 << 11) | 20) & 0xFu; }
#define XB_SPIN(cond, bar) do { unsigned _sp = 0; while (cond) { __builtin_amdgcn_s_sleep(1); \
    if ((++_sp & 255u) == 0u) { if (xb_ld(&(bar)[XB_TMO])) break; if (_sp > XB_SPIN_CAP) { atomicAdd(&(bar)[XB_TMO], 1u); break; } } } } while (0)

struct XcdBarrier {
    unsigned* bar; unsigned x;
    volatile LAS unsigned* st;
};

__device__ __forceinline__ XcdBarrier xcd_barrier_post(unsigned* bar, volatile LAS unsigned* st) {
    XcdBarrier b; b.bar = bar; b.x = xb_xcc_id(); b.st = st;
    if (threadIdx.x == 0) (void)xb_add(&bar[XB_XCNT(b.x)], 1u);
    return b;
}
__device__ __forceinline__ void xcd_barrier_complete(unsigned* bar, unsigned x, unsigned& nloc, unsigned& nx) {
    const unsigned G = gridDim.x * gridDim.y * gridDim.z;
    unsigned sum, cnt, mine, sp = 0u;
    for (;;) {
        sum = 0u; cnt = 0u; mine = 0u;
#pragma unroll
        for (unsigned j = 0; j < 16; ++j) { const unsigned c = xb_ld(&bar[XB_XCNT(j)]); sum += c; cnt += (c > 0u) ? 1u : 0u; mine = (j == x) ? c : mine; }
        if (sum == G) break;
        __builtin_amdgcn_s_sleep(1);
        if ((++sp & 255u) == 0u) { if (xb_ld(&bar[XB_TMO])) break; if (sp > XB_SPIN_CAP) { atomicAdd(&bar[XB_TMO], 1u); break; } }
    }
    nloc = mine > 0u ? mine : 1u; nx = cnt > 0u ? cnt : 1u;
}

__device__ __forceinline__ void xcd_barrier(const XcdBarrier& b) {
    asm volatile("s_waitcnt vmcnt(0)" ::: "memory");
    __syncthreads();
    if (threadIdx.x == 0) {
        unsigned* bar = b.bar;
        __builtin_amdgcn_s_waitcnt(0);
        unsigned nloc = b.st[0], nx = b.st[1];
        if (nloc == 0u) { xcd_barrier_complete(bar, b.x, nloc, nx); b.st[0] = nloc; b.st[1] = nx; }
        const unsigned old = xb_add(&bar[XB_XSUB(b.x)], 1u);
        const unsigned gen = old / nloc;
        if (old + 1u == (gen + 1u) * nloc) {
            __builtin_amdgcn_fence(__ATOMIC_RELEASE, "agent");
            asm volatile("s_waitcnt vmcnt(0)" ::: "memory");
            const unsigned og = xb_add(&bar[XB_TOP], 1u);
            const unsigned tg = og / nx;
            if (og + 1u == (tg + 1u) * nx) xb_add(&bar[XB_TOPGEN], 1u);
            else XB_SPIN(xb_ld(&bar[XB_TOPGEN]) == tg, bar);
            __builtin_amdgcn_fence(__ATOMIC_ACQUIRE, "agent");
            xb_add(&bar[XB_XGEN(b.x)], 1u);
            asm volatile("s_waitcnt vmcnt(0)" ::: "memory");
        } else {
            XB_SPIN(xb_ld(&bar[XB_XGEN(b.x)]) == gen, bar);
            __builtin_amdgcn_fence(__ATOMIC_ACQUIRE, "agent");
            asm volatile("s_waitcnt vmcnt(0)" ::: "memory");
        }
    }
    __syncthreads();
}

struct Params { const float* in[27]; float* out; unsigned char* ws; int ph_lo, ph_hi; };
enum { I_X = 0, I_WIN, I_GMNG, I_GMNB, I_GMWS, I_GMBS, I_CONVW, I_ALOG, I_DTB, I_GDNNG, I_MLIB, I_MLFB, I_MLNG, I_WBR, I_WOUT, I_LN1G, I_LN1B,
       I_WR, I_RB, I_WG, I_WU, I_WD, I_SG, I_SU, I_SD, I_LN2G, I_LN2B };

using pg8::f32x4; using pg8::u32x4; using pg8::Unit; using pg8::HALF; using pg8::BM;

struct EpiMergeH {
    static constexpr bool PERM = true, AFTER_DRAIN = false; static constexpr int MID = BW / pg8::BK;
    const bf16* Z; bf16* msum;
    __device__ __forceinline__ void mid(f32x4 (&acc)[2][2][4][2], const Unit& u, int j, int wr, int wc, int fr, int fq) const {
        int row0 = u.pm * BM + wr * 64 + fr; const int col0 = u.pn * BM + wc * 32 + 8 * fq; asm volatile("" : "+v"(row0));
        const bf16* zp = Z + ZC_GATE + (size_t)(j - 1) * D + col0;
#pragma unroll
        for (int am = 0; am < 4; ++am) { const int ai = am >> 1, m0 = (am & 1) * 2; v4u ga[2][2], gb[2][2];
#pragma unroll
            for (int m = 0; m < 2; ++m)
#pragma unroll
                for (int bj = 0; bj < 2; ++bj) { const bf16* q = zp + (size_t)(row0 + ai * HALF + (m0 + m) * 16) * ZC + bj * HALF; ga[m][bj] = *(const v4u*)q; gb[m][bj] = *(const v4u*)(q + D); }
#pragma unroll
            for (int m = 0; m < 2; ++m)
#pragma unroll
                for (int bj = 0; bj < 2; ++bj) { float a[8], b[8]; unpack8(ga[m][bj], a); unpack8(gb[m][bj], b);
#pragma unroll
                    for (int i = 0; i < 8; ++i) { const float ea = __builtin_amdgcn_exp2f(fmaxf(a[i], -60.f) * -1.44269504f), eb = __builtin_amdgcn_exp2f(fmaxf(b[i], -60.f) * -1.44269504f);
                        acc[ai][bj][m0 + m][i >> 2][i & 3] *= (1.f + eb) * __builtin_amdgcn_rcpf(1.f + ea); } }
            asm volatile("" ::: "memory"); }
    }
    __device__ __forceinline__ void operator()(const f32x4 (&acc)[2][2][4][2], const Unit& u, int wr, int wc, int fr, int fq) const {
        const int row0 = u.pm * BM + wr * 64 + fr, col0 = u.pn * BM + wc * 32 + 8 * fq;
#pragma unroll
        for (int ai = 0; ai < 2; ++ai) { v4u gg[4][2];
#pragma unroll
            for (int m = 0; m < 4; ++m)
#pragma unroll
                for (int bj = 0; bj < 2; ++bj) gg[m][bj] = *(const v4u*)(Z + (size_t)(row0 + ai * HALF + m * 16) * ZC + ZC_GATE + 3 * D + col0 + bj * HALF);
#pragma unroll
            for (int m = 0; m < 4; ++m)
#pragma unroll
                for (int bj = 0; bj < 2; ++bj) { const size_t row = (size_t)(row0 + ai * HALF + m * 16); const int col = col0 + bj * HALF; float gl[8]; unpack8(gg[m][bj], gl);
                    f32x4 v0 = acc[ai][bj][m][0], v1 = acc[ai][bj][m][1];
#pragma unroll
                    for (int j = 0; j < 4; ++j) { v0[j] *= sigmoidf_(gl[j]); v1[j] *= sigmoidf_(gl[4 + j]); }
                    unsigned w0 = 0, w1 = 0; w0 = __builtin_amdgcn_cvt_pk_fp8_f32(v0[0], v0[1], w0, false); w0 = __builtin_amdgcn_cvt_pk_fp8_f32(v0[2], v0[3], w0, true); w1 = __builtin_amdgcn_cvt_pk_fp8_f32(v1[0], v1[1], w1, false); w1 = __builtin_amdgcn_cvt_pk_fp8_f32(v1[2], v1[3], w1, true);
                    *(v2u*)((unsigned char*)msum + row * D + col) = (v2u){w0, w1}; }
            asm volatile("" ::: "memory"); }
    }
};
struct EpiResid {
    static constexpr bool PERM = false, AFTER_DRAIN = false; static constexpr int MID = 0;
    const float* X; float* Y; float sc;
    __device__ __forceinline__ void operator()(const f32x4 (&acc)[2][2][4][2], const Unit& u, int wr, int wc, int fr, int fq) const {
        const int row0 = u.pm * BM + wr * 64 + fr, col0 = u.pn * BM + wc * 32 + 4 * fq;
#pragma unroll
        for (int ai = 0; ai < 2; ++ai)
#pragma unroll
            for (int m = 0; m < 4; ++m) { const size_t off = (size_t)(row0 + ai * HALF + m * 16) * D + col0;
#pragma unroll
                for (int bj = 0; bj < 2; ++bj)
#pragma unroll
                    for (int n = 0; n < 2; ++n) { const f32x4 xv = *(const f32x4*)(X + off + bj * HALF + n * 16); *(f32x4*)(Y + off + bj * HALF + n * 16) = xv * ALPHA + acc[ai][bj][m][n] * sc; } }
    }
};
struct MoeTab {
    LAS int* t; LAS unsigned short* tok; LAS float* wt; LAS unsigned char* mte;
    __device__ __forceinline__ MoeTab(LAS unsigned char* lds) : t((LAS int*)(lds + TAB_OFF)), tok((LAS unsigned short*)(lds + TAB_OFF + 1024)), wt((LAS float*)(lds + TAB_OFF + 5120)), mte((LAS unsigned char*)(lds + TAB_OFF + 13312)) {}
};
__device__ __forceinline__ void moe_tables(const MoeTab& M, const unsigned* cnt  , int tid, int lane, int wave) {
    __syncthreads();
    if (wave == 0) { const int c = (int)cnt[64 * lane]; const int tiles = (c + 255) >> 8; const float incl = wave_scan_incl((float)tiles);
        M.t[80 + lane] = c; M.t[lane] = (int)incl - tiles; if (lane == 63) { M.t[64] = (int)incl; M.t[65] = (int)incl + T / 256; M.t[80 + 64] = T; } }
    __syncthreads();
    const int Mt = M.t[65];
    for (int mt = tid; mt < Mt; mt += 512) { int e = 0;
        for (int k = 1; k <= 64; ++k) e = (M.t[k] <= mt) ? k : e;
        M.mte[mt] = (unsigned char)e; }
    __syncthreads();
}
struct UpOrder {
    MoeTab M; int n;
    __device__ __forceinline__ bool next(int i, Unit& u) const { if (i >= n) return false; u.pm = M.t[168 + i]; u.pn = M.t[176 + i]; u.aux = i; return true; }
    __device__ __forceinline__ int row_token(int i, int r) const { return (int)M.tok[i * 256 + r]; }
    __device__ __forceinline__ void a_ready(const Unit&) const {}
    __device__ __forceinline__ void done(const Unit&) const {}
};
__device__ __forceinline__ int up_order_build(const MoeTab& M, const int* LIST, const float* WL, int wg, int G, int tid) {
    const int U = 4 * M.t[65];
    if (tid < 8) { const int L = tid * G + wg; if (L < U) { const int mt = L >> 2, q = L & 3, e = M.mte[mt]; M.t[168 + tid] = mt; M.t[176 + tid] = e * 4 + q; M.t[184 + tid] = e; M.t[192 + tid] = mt - M.t[e]; } }
    int n = 0;
#pragma unroll
    for (int i = 0; i < 8; ++i) n += (i * G + wg < U) ? 1 : 0;
    __syncthreads();
    for (int idx = tid; idx < n * 256; idx += 512) { const int i = idx >> 8, r = idx & 255, e = M.t[184 + i], li = M.t[192 + i] * 256 + r;
        int tk = 0; float w = 0.f;
        if (e < NE) { if (li < M.t[80 + e]) { tk = LIST[e * T + li]; w = WL[e * T + li]; } } else { tk = li; w = 1.f; }
        M.tok[idx] = (unsigned short)tk; M.wt[idx] = w; }
    __syncthreads();
    return n;
}
struct EpiGluSparse {
    static constexpr bool PERM = true, AFTER_DRAIN = false; static constexpr int MID = 0;
    LAS const float* wt; bf16* H;
    __device__ __forceinline__ void operator()(const f32x4 (&acc)[2][2][4][2], const Unit& u, int wr, int wc, int fr, int fq) const {
        const int q = u.pn & 3; const int rl0 = wr * 64 + fr, col0 = q * 128 + wc * 32 + 8 * fq;
#pragma unroll
        for (int ai = 0; ai < 2; ++ai)
#pragma unroll
            for (int m = 0; m < 4; ++m) { const int rl = rl0 + ai * HALF + m * 16; const float c = wt[u.aux * 256 + rl]; float h[8];
#pragma unroll
                for (int n = 0; n < 2; ++n)
#pragma unroll
                    for (int j = 0; j < 4; ++j) h[4 * n + j] = siluf_(acc[ai][0][m][n][j] * UPSC) * (acc[ai][1][m][n][j] * UPSC) * c;
                u32x4 w; w.x = pk2(h[0], h[1]); w.y = pk2(h[2], h[3]); w.z = pk2(h[4], h[5]); w.w = pk2(h[6], h[7]);
                *(u32x4*)(H + ((size_t)u.pm * 256 + rl) * ED + col0) = w; }
    }
};
struct DownOrder {
    MoeTab M; int G, c, U;
    __device__ __forceinline__ bool next(int i, Unit& u) const { const int L = i * G + c; if (L >= U) return false; const int mt = L >> 3; u.pm = mt; u.pn = (int)M.mte[mt] * 8 + (L & 7); u.aux = 0; return true; }
    __device__ __forceinline__ void a_ready(const Unit&) const {}
    __device__ __forceinline__ void done(const Unit&) const {}
};
struct EpiYexp {
    static constexpr bool PERM = true, AFTER_DRAIN = false; static constexpr int MID = 0;
    bf16* Y;
    __device__ __forceinline__ void operator()(const f32x4 (&acc)[2][2][4][2], const Unit& u, int wr, int wc, int fr, int fq) const {
        const int row0 = u.pm * BM + wr * 64 + fr, col0 = (u.pn & 7) * BM + wc * 32 + 8 * fq;
#pragma unroll
        for (int ai = 0; ai < 2; ++ai)
#pragma unroll
            for (int m = 0; m < 4; ++m) { bf16* rowp = Y + (size_t)(row0 + ai * HALF + m * 16) * D + col0;
#pragma unroll
                for (int bj = 0; bj < 2; ++bj) { const f32x4 v0 = acc[ai][bj][m][0], v1 = acc[ai][bj][m][1];
                    u32x4 w; w.x = pk2(v0[0], v0[1]); w.y = pk2(v0[2], v0[3]); w.z = pk2(v1[0], v1[1]); w.w = pk2(v1[2], v1[3]); *(u32x4*)(rowp + bj * HALF) = w; } }
    }
};

struct TrItem { const float* src; bf16* dst; unsigned sld, dld; int f8; };
__device__ __forceinline__ void tr_load(const TrItem& t, int lane, v4f (&v)[8]) { const int r8 = lane >> 3, c4 = lane & 7;
#pragma unroll
    for (int i = 0; i < 8; ++i) v[i] = *(const v4f*)(t.src + (size_t)(8 * i + r8) * t.sld + 4 * c4); }
__device__ __forceinline__ void tr_store(const TrItem& t, const v4f (&v)[8], LAS float* scr, int lane) {
    { const int r8 = lane >> 3, c4 = lane & 7;
#pragma unroll
      for (int i = 0; i < 8; ++i) { LAS float* d = scr + (8 * i + r8) * 33 + 4 * c4; d[0] = v[i].x; d[1] = v[i].y; d[2] = v[i].z; d[3] = v[i].w; } }
    LDS_WAIT(); asm volatile("" ::: "memory");
    if (t.f8) {
        const int c = lane & 3;
#pragma unroll
        for (int j = 0; j < 2; ++j) { const int n = (lane >> 2) + 16 * j; const LAS float* s = scr + (16 * c) * 33 + n; unsigned w[4];
#pragma unroll
            for (int q = 0; q < 4; ++q) { unsigned x = 0; x = __builtin_amdgcn_cvt_pk_fp8_f32(s[(4 * q) * 33] * 64.f, s[(4 * q + 1) * 33] * 64.f, x, false); x = __builtin_amdgcn_cvt_pk_fp8_f32(s[(4 * q + 2) * 33] * 64.f, s[(4 * q + 3) * 33] * 64.f, x, true); w[q] = x; }
            *(v4u*)((unsigned char*)t.dst + (size_t)n * t.dld + 16 * c) = (v4u){w[0], w[1], w[2], w[3]}; }
    } else {
        const int c = lane & 7;
#pragma unroll
        for (int j = 0; j < 4; ++j) { const int n = (lane >> 3) + 8 * j; const LAS float* s = scr + (8 * c) * 33 + n;
            v4u o; o.x = pk2(s[0 * 33], s[1 * 33]); o.y = pk2(s[2 * 33], s[3 * 33]); o.z = pk2(s[4 * 33], s[5 * 33]); o.w = pk2(s[6 * 33], s[7 * 33]);
            *(v4u*)(t.dst + (size_t)n * t.dld + 8 * c) = o; }
    }
    LDS_WAIT(); asm volatile("" ::: "memory");
}
template <int PART> __device__ __forceinline__ TrItem tr_decode(const Params& p, int l, int it) {
    unsigned char* ws = p.ws;
    constexpr int N_IN = (ZC / 32) * (D / 64), N_BR = 4 * (BW / 64) * (D / 32), N_OUT = (D / 64) * (D / 32), N_UP = NEX * 2 * (D / 64) * (ED / 32);
    int r = it; TrItem t; t.f8 = 0;
    if (PART == 0) {
        const float* w_in = p.in[I_WIN] + (size_t)l * D * INC; const float* w_br = p.in[I_WBR] + (size_t)l * 4 * BW * D; const float* w_out = p.in[I_WOUT] + (size_t)l * D * D;
        bf16* WIN = (bf16*)(ws + WS_WIN); bf16* WBR = (bf16*)(ws + WS_WBR); bf16* WOUT = (bf16*)(ws + WS_WOUT);
        if (r < N_IN) { const int kb = r / (ZC / 32), n0 = (r % (ZC / 32)) * 32, k0 = kb * 64; const int sc = n0 + (n0 >= ZC_GATE ? 16 : (n0 >= ZC_MLQ ? 8 : 0));
            t.src = w_in + (size_t)k0 * INC + sc; t.sld = INC; t.dst = (bf16*)((unsigned char*)WIN + (size_t)n0 * D + k0); t.dld = D; t.f8 = 1; return t; } r -= N_IN;
        if (r < N_BR) { const int g = r / 512, rr = r % 512, k0 = (rr / 64) * 64, n0 = (rr % 64) * 32;
            t.src = w_br + ((size_t)g * BW + k0) * D + n0; t.sld = D; t.dst = WBR + (size_t)n0 * BRW + g * BW + k0; t.dld = BRW; return t; } r -= N_BR;
        { const int k0 = (r / 64) * 64, n0 = (r % 64) * 32; t.src = w_out + (size_t)k0 * D + n0; t.sld = D; t.dst = (bf16*)((unsigned char*)WOUT + (size_t)n0 * D + k0); t.dld = D; t.f8 = 1; return t; }
    } else {
        const float* w_g = p.in[I_WG] + (size_t)l * NE * D * ED; const float* w_u = p.in[I_WU] + (size_t)l * NE * D * ED; const float* w_d = p.in[I_WD] + (size_t)l * NE * ED * D;
        const float* s_g = p.in[I_SG] + (size_t)l * D * ED; const float* s_u = p.in[I_SU] + (size_t)l * D * ED; const float* s_d = p.in[I_SD] + (size_t)l * ED * D;
        bf16* WUP = (bf16*)(ws + WS_WUP); bf16* WDN = (bf16*)(ws + WS_WDN);
        if (r < N_UP) { const int e = r / 1024, rr = r % 1024, mat = rr / 512, r2 = rr % 512, k0 = (r2 / 16) * 64, n0 = (r2 % 16) * 32;
            const float* sb = (e < NE) ? ((mat ? w_u : w_g) + (size_t)e * D * ED) : (mat ? s_u : s_g);
            const int drow = e * 1024 + (n0 / 128) * 256 + mat * 128 + (n0 % 128);
            t.src = sb + (size_t)k0 * ED + n0; t.sld = ED;
#if MOE_UP_FP8
            t.dst = (bf16*)((unsigned char*)WUP + (size_t)drow * D + k0); t.dld = D; t.f8 = 1; return t; }
#else
            t.dst = WUP + (size_t)drow * D + k0; t.dld = D; return t; }
#endif
        r -= N_UP;
        { const int e = r / 512, rr = r % 512, k0 = (rr / 64) * 64, n0 = (rr % 64) * 32;
            const float* sb = (e < NE) ? (w_d + (size_t)e * ED * D) : s_d;
            t.src = sb + (size_t)k0 * D + n0; t.sld = D; t.dst = WDN + ((size_t)e * D + n0) * ED + k0; t.dld = ED; return t; }
    }
}
template <int PART> __device__ __forceinline__ void phase_convert(const Params& p, int l, LAS unsigned char* lds, int gw, int NGW, int wave, int lane) {
    constexpr int N_IN = (ZC / 32) * (D / 64), N_BR = 4 * (BW / 64) * (D / 32), N_OUT = (D / 64) * (D / 32), N_UP = NEX * 2 * (D / 64) * (ED / 32), N_DN = NEX * (ED / 64) * (D / 32);
    constexpr int NITEMS = (PART == 0) ? (N_IN + N_BR + N_OUT) : (N_UP + N_DN);
    LAS float* scr = (LAS float*)(lds + wave * 16384);
    if (gw >= NITEMS) return;
    TrItem cur = tr_decode<PART>(p, l, gw); v4f va[8], vb[8];
    tr_load(cur, lane, va);
    for (int it = gw; it < NITEMS; it += 2 * NGW) {
        const int i1 = it + NGW, i2 = it + 2 * NGW; TrItem nx = cur;
        if (i1 < NITEMS) { nx = tr_decode<PART>(p, l, i1); } tr_load(nx, lane, vb);
        tr_store(cur, va, scr, lane);
        if (i1 >= NITEMS) break;
        cur = nx; if (i2 < NITEMS) { cur = tr_decode<PART>(p, l, i2); } tr_load(cur, lane, va);
        tr_store(nx, vb, scr, lane);
        if (i2 >= NITEMS) break;
    }
}
__device__ __forceinline__ void phase_xprep(const Params& p, int l, const float* xin, LAS unsigned char* lds, int gw, int NGW, int tid, int lane) {
    const float* w_in = p.in[I_WIN] + (size_t)l * D * INC;
    constexpr int XP = 2052; LAS float* xt = (LAS float*)lds; LAS float* part = (LAS float*)lds;
    const int wave = tid >> 6, n_l = lane & 15, kq = lane >> 4, wg = gw >> 3, G = NGW >> 3;
    const int colw = n_l < 8 ? 4608 + n_l : 6152 + (n_l - 8);
    float bw[64];
#pragma unroll
    for (int q = 0; q < 64; ++q) bw[q] = w_in[(size_t)(256 * wave + 16 * (q >> 2) + 4 * kq + (q & 3)) * INC + colw];
    unsigned char* XB = p.ws + WS_XB; float* SMALL = (float*)(p.ws + WS_SMALL);
    __syncthreads();
    for (int tg = wg; tg < T / 16; tg += G) {
        {   v4f va[8], vb[8]; const size_t m0 = (size_t)tg * 16 + 2 * wave;
            const v4f* xa = (const v4f*)(xin + m0 * D) + lane; const v4f* xb = (const v4f*)(xin + (m0 + 1) * D) + lane;
#pragma unroll
            for (int j = 0; j < 8; ++j) { va[j] = xa[64 * j]; vb[j] = xb[64 * j]; }
#pragma unroll
            for (int rr = 0; rr < 2; ++rr) { unsigned* xo = (unsigned*)(XB + (m0 + rr) * D) + lane;
#pragma unroll
                for (int j = 0; j < 8; ++j) { const v4f v = rr ? vb[j] : va[j]; unsigned w = 0; w = __builtin_amdgcn_cvt_pk_fp8_f32(v.x, v.y, w, false); w = __builtin_amdgcn_cvt_pk_fp8_f32(v.z, v.w, w, true); xo[64 * j] = w;
                    *(LAS v4f*)(xt + (2 * wave + rr) * XP + 4 * lane + 256 * j) = v; } } }
        __syncthreads();
        {   pg8::f32x4 acc[4];
#pragma unroll
            for (int i = 0; i < 4; ++i) acc[i] = (pg8::f32x4){0.f, 0.f, 0.f, 0.f};
            const LAS float* xa = xt + n_l * XP + 256 * wave + 4 * kq;
#pragma unroll
            for (int s2 = 0; s2 < 16; ++s2) { const v4f a4 = *(const LAS v4f*)(xa + 16 * s2);
                acc[0] = __builtin_amdgcn_mfma_f32_16x16x4f32(a4.x, bw[4 * s2 + 0], acc[0], 0, 0, 0); acc[1] = __builtin_amdgcn_mfma_f32_16x16x4f32(a4.y, bw[4 * s2 + 1], acc[1], 0, 0, 0);
                acc[2] = __builtin_amdgcn_mfma_f32_16x16x4f32(a4.z, bw[4 * s2 + 2], acc[2], 0, 0, 0); acc[3] = __builtin_amdgcn_mfma_f32_16x16x4f32(a4.w, bw[4 * s2 + 3], acc[3], 0, 0, 0); }
            const pg8::f32x4 tot = (acc[0] + acc[1]) + (acc[2] + acc[3]);
            __syncthreads();
#pragma unroll
            for (int j = 0; j < 4; ++j) part[(wave * 16 + 4 * kq + j) * 16 + n_l] = tot[j]; }
        __syncthreads();
        if (tid < 256) { float a = 0.f;
#pragma unroll
            for (int w = 0; w < 8; ++w) a += part[w * 256 + tid];
            SMALL[(size_t)tg * 256 + tid] = a; }
        __syncthreads();
    }
}


typedef short bf16x8_t __attribute__((ext_vector_type(8)));
__device__ __forceinline__ void ml_pre_item(const Params& p, int l, LAS unsigned char* lds, int item, int tid, int wave, int lane) {
    const int h = item & 3, n = item >> 2; const size_t t0 = (size_t)n * 64;
    const bf16* Z = (const bf16*)(p.ws + WS_Z); const float* SMALL = (const float*)(p.ws + WS_SMALL);
    bf16* MQ = (bf16*)(p.ws + WS_MQ) + (size_t)item * 4096; bf16* MS = (bf16*)(p.ws + WS_MS) + (size_t)item * 4096; bf16* MK = (bf16*)(p.ws + WS_MK) + (size_t)item * 4096;
    bf16* MV = (bf16*)(p.ws + WS_MV) + (size_t)item * 9216; float* MFL = (float*)(p.ws + WS_MFL);
    LAS float* qs = (LAS float*)lds;
    LAS float* ks = qs + 64 * 65;
    LAS float* bs = ks + 64 * 65;
    LAS unsigned short* vs = (LAS unsigned short*)(bs + 128);
    { const int tk = tid >> 3, c8 = tid & 7; float f[8];
      unpack8(*(const v4u*)(Z + (t0 + tk) * ZC + ZC_MLQ + h * 64 + 8 * c8), f);
#pragma unroll
      for (int i = 0; i < 8; ++i) qs[tk * 65 + 8 * c8 + i] = f[i];
      unpack8(*(const v4u*)(Z + (t0 + tk) * ZC + ZC_MLK + h * 64 + 8 * c8), f);
#pragma unroll
      for (int i = 0; i < 8; ++i) ks[tk * 65 + 8 * c8 + i] = f[i]; }
#pragma unroll
    for (int r = 0; r < 2; ++r) { const int idx = tid + 512 * r, tk = idx >> 4, c8 = idx & 15;
        *(LAS v4u*)(vs + tk * 136 + 8 * c8) = *(const v4u*)(Z + (t0 + tk) * ZC + ZC_MLV + h * 128 + 8 * c8); }
    if (wave == 0) { const float fp = SMALL[(t0 + lane) * 16 + 12 + h] + p.in[I_MLFB][l * 4 + h]; const float lf = -softplusf_(-fp);
        bs[lane] = wave_scan_incl(lf); bs[64 + lane] = SMALL[(t0 + lane) * 16 + 8 + h] + p.in[I_MLIB][l * 4 + h]; }
    __syncthreads();
    const float blast = bs[63];
    { const int i = tid >> 3, jb = tid & 7; const float bi = bs[i];
      { const float e = __expf(bi) * 0.125f; float o[8];
#pragma unroll
        for (int x = 0; x < 8; ++x) o[x] = qs[i * 65 + 8 * jb + x] * e;
        v4u w; w.x = pk2(o[0], o[1]); w.y = pk2(o[2], o[3]); w.z = pk2(o[4], o[5]); w.w = pk2(o[6], o[7]); *(v4u*)(MQ + i * 64 + 8 * jb) = w; }
      { float d[8];
#pragma unroll
        for (int x = 0; x < 8; ++x) d[x] = 0.f;
        if (8 * jb <= i) {
            for (int dd = 0; dd < 64; ++dd) { const float qv = qs[i * 65 + dd];
#pragma unroll
                for (int x = 0; x < 8; ++x) d[x] += qv * ks[(8 * jb + x) * 65 + dd]; }
#pragma unroll
            for (int x = 0; x < 8; ++x) { const int j = 8 * jb + x; d[x] = (j <= i) ? __expf(bi - bs[j] + bs[64 + j]) * d[x] * 0.125f : 0.f; } }
        v4u w; w.x = pk2(d[0], d[1]); w.y = pk2(d[2], d[3]); w.z = pk2(d[4], d[5]); w.w = pk2(d[6], d[7]); *(v4u*)(MS + i * 64 + 8 * jb) = w; }
      { float o[8];
#pragma unroll
        for (int x = 0; x < 8; ++x) { const int j = 8 * jb + x; o[x] = ks[j * 65 + i] * __expf(blast - bs[j] + bs[64 + j]); }
        v4u w; w.x = pk2(o[0], o[1]); w.y = pk2(o[2], o[3]); w.z = pk2(o[4], o[5]); w.w = pk2(o[6], o[7]); *(v4u*)(MK + i * 64 + 8 * jb) = w; }
    }
    { const int c = tid >> 2, jq = tid & 3; unsigned w[8];
#pragma unroll
      for (int x = 0; x < 8; ++x) w[x] = (unsigned)vs[(16 * jq + 2 * x) * 136 + c] | ((unsigned)vs[(16 * jq + 2 * x + 1) * 136 + c] << 16);
      *(v4u*)(MV + c * 64 + 16 * jq) = (v4u){w[0], w[1], w[2], w[3]}; *(v4u*)(MV + c * 64 + 16 * jq + 8) = (v4u){w[4], w[5], w[6], w[7]};
      if (tid < 64) { const int c2 = 128 + (tid >> 2); const unsigned one = (c2 == 128) ? 0x3F803F80u : 0u;
          *(v4u*)(MV + c2 * 64 + 16 * jq) = (v4u){one, one, one, one}; *(v4u*)(MV + c2 * 64 + 16 * jq + 8) = (v4u){one, one, one, one}; } }
    if (tid == 0) MFL[item] = __expf(blast);
    __syncthreads();
}
struct MlFrags { bf16x8_t q[2], s[2], kt[2], vt[2]; float fl; };
__device__ __forceinline__ void ml_load(MlFrags& F, const Params& p, int item, int offA, int offV) {
    const bf16* MQ = (const bf16*)(p.ws + WS_MQ) + (size_t)item * 4096; const bf16* MS = (const bf16*)(p.ws + WS_MS) + (size_t)item * 4096; const bf16* MK = (const bf16*)(p.ws + WS_MK) + (size_t)item * 4096;
    const bf16* MV = (const bf16*)(p.ws + WS_MV) + (size_t)item * 9216;
#pragma unroll
    for (int ks = 0; ks < 2; ++ks) { F.q[ks] = *(const bf16x8_t*)(MQ + offA + 32 * ks); F.s[ks] = *(const bf16x8_t*)(MS + offA + 32 * ks); F.kt[ks] = *(const bf16x8_t*)(MK + offA + 32 * ks); F.vt[ks] = *(const bf16x8_t*)(MV + offV + 32 * ks); }
    F.fl = ((const float*)(p.ws + WS_MFL))[item];
}
__device__ __forceinline__ void ml_seq(const Params& p, LAS unsigned char* lds, int wgi, int wave, int lane) {
    const int u = wgi * 2 + (wave >> 2), wi = wave & 3, h = u / 9, sl = u % 9, g = lane >> 4, c = lane & 15;
    LAS unsigned short* CT = (LAS unsigned short*)(lds + (wave >> 2) * 4096);
    float* HO = (float*)(p.ws + WS_HO); float* HDEN = (float*)(p.ws + WS_HDEN);
    const int offA = (16 * wi + c) * 64 + 8 * g, offV = (16 * sl + c) * 64 + 8 * g;
    *(LAS v2u*)(CT + c * 64 + 16 * wi + 4 * g) = (v2u){0u, 0u};
    pg8::f32x4 Cacc = {0.f, 0.f, 0.f, 0.f};
    __syncthreads();
    MlFrags F0, F1;
    ml_load(F0, p, h, offA, offV);
#define ML_STEP(F, n_) do { const int cur = (n_) & 1; \
        const bf16x8_t c0 = *(const LAS bf16x8_t*)(CT + cur * 1024 + c * 64 + 8 * g), c1 = *(const LAS bf16x8_t*)(CT + cur * 1024 + c * 64 + 32 + 8 * g); \
        pg8::f32x4 num = {0.f, 0.f, 0.f, 0.f}; \
        num = __builtin_amdgcn_mfma_f32_16x16x32_bf16(F.q[0], c0, num, 0, 0, 0); num = __builtin_amdgcn_mfma_f32_16x16x32_bf16(F.q[1], c1, num, 0, 0, 0); \
        num = __builtin_amdgcn_mfma_f32_16x16x32_bf16(F.s[0], F.vt[0], num, 0, 0, 0); num = __builtin_amdgcn_mfma_f32_16x16x32_bf16(F.s[1], F.vt[1], num, 0, 0, 0); \
        Cacc = Cacc * F.fl; \
        Cacc = __builtin_amdgcn_mfma_f32_16x16x32_bf16(F.kt[0], F.vt[0], Cacc, 0, 0, 0); Cacc = __builtin_amdgcn_mfma_f32_16x16x32_bf16(F.kt[1], F.vt[1], Cacc, 0, 0, 0); \
        { v2u w; w.x = pk2(Cacc[0], Cacc[1]); w.y = pk2(Cacc[2], Cacc[3]); *(LAS v2u*)(CT + (cur ^ 1) * 1024 + c * 64 + 16 * wi + 4 * g) = w; } \
        { const size_t tb = (size_t)(n_) * 64 + 16 * wi + 4 * g; \
          if (sl < 8) { _Pragma("unroll") for (int r = 0; r < 4; ++r) HO[(tb + r) * BW + h * 128 + 16 * sl + c] = num[r]; } \
          else if (c == 0) { _Pragma("unroll") for (int r = 0; r < 4; ++r) HDEN[(tb + r) * 4 + h] = num[r]; } } \
        LDS_BAR(); } while (0)
    for (int n = 0; n < T / 64; n += 2) {
        ml_load(F1, p, (n + 1) * 4 + h, offA, offV);
        ML_STEP(F0, n);
        ml_load(F0, p, ((n + 2 < T / 64) ? n + 2 : n) * 4 + h, offA, offV);
        ML_STEP(F1, n + 1);
    }
#undef ML_STEP
}


constexpr int QP = 132;
__device__ __forceinline__ void gdn_pre_item(const Params& p, int l, LAS unsigned char* lds, int item, int tid, int wave, int lane) {
    const int h = item & 3, n = item >> 2; const size_t t0 = (size_t)n * 64;
    const bf16* Z = (const bf16*)(p.ws + WS_Z); const float* SMALL = (const float*)(p.ws + WS_SMALL);
    float* GU = (float*)(p.ws + WS_GU) + (size_t)item * 8192; bf16* GNW = (bf16*)(p.ws + WS_GNW) + (size_t)item * 8192; bf16* GQG = (bf16*)(p.ws + WS_GQG) + (size_t)item * 8192;
    bf16* GAT = (bf16*)(p.ws + WS_GAT) + (size_t)item * 4096; bf16* GKT = (bf16*)(p.ws + WS_GKT) + (size_t)item * 8192; float* GDL = (float*)(p.ws + WS_GDL);
    const float* cw = p.in[I_CONVW] + (size_t)l * 4 * 1536;
    LAS float* qs = (LAS float*)lds; LAS float* ks = qs + 64 * QP; LAS float* vs = ks + 64 * QP; LAS float* Ls = vs + 64 * QP;   LAS float* gcs = Ls + 64 * 68; LAS float* bts = gcs + 64; LAS float* btg = bts + 64;
    { const int tk = tid >> 3, part = tid & 7;
#pragma unroll 1
      for (int i = 0; i < 3; ++i) { float a[16];
#pragma unroll
        for (int x = 0; x < 16; ++x) a[x] = 0.f;
#pragma unroll
        for (int j = 0; j < 4; ++j) { const long tt = (long)t0 + tk - 3 + j; if (tt >= 0) {
            const bf16* src = Z + (size_t)tt * ZC + ZC_GDN + i * 512 + h * 128 + 16 * part; float x0[8], x1[8]; unpack8(*(const v4u*)src, x0); unpack8(*(const v4u*)(src + 8), x1);
            const float* wp = cw + j * 1536 + i * 512 + h * 128 + 16 * part;
#pragma unroll
            for (int x = 0; x < 8; ++x) { a[x] += wp[x] * x0[x]; a[8 + x] += wp[8 + x] * x1[x]; } } }
        float ss = 0.f;
#pragma unroll
        for (int x = 0; x < 16; ++x) { a[x] = siluf_(a[x]); ss += a[x] * a[x]; }
        if (i < 2) { ss = sum8(ss); const float r = rsqrtf(ss + 1e-6f) * (i == 0 ? 0.08838834764831845f : 1.f);
#pragma unroll
            for (int x = 0; x < 16; ++x) a[x] *= r; }
        LAS float* dst = (i == 0 ? qs : (i == 1 ? ks : vs)) + tk * QP + 16 * part;
#pragma unroll
        for (int x4 = 0; x4 < 4; ++x4) *(LAS v4f*)(dst + 4 * x4) = (v4f){a[4 * x4], a[4 * x4 + 1], a[4 * x4 + 2], a[4 * x4 + 3]}; } }
    if (wave == 0) { const float bb = SMALL[(t0 + lane) * 16 + h], aa = SMALL[(t0 + lane) * 16 + 4 + h];
        const float g = -__expf(p.in[I_ALOG][l * 4 + h]) * softplusf_(aa + p.in[I_DTB][l * 4 + h]);
        const float gc = wave_scan_incl(g), bt = sigmoidf_(bb); gcs[lane] = gc; bts[lane] = bt; btg[lane] = bt * __expf(gc); }
    __syncthreads();
    { const int i = tid >> 3, jb = tid & 7; const float gi = gcs[i], bi = bts[i]; float dk[8], dq[8];
#pragma unroll
      for (int x = 0; x < 8; ++x) { dk[x] = 0.f; dq[x] = 0.f; }
      if (8 * jb <= i) {
#pragma unroll 2
          for (int d4 = 0; d4 < 32; ++d4) { const v4f qi = *(const LAS v4f*)(qs + i * QP + 4 * d4), ki = *(const LAS v4f*)(ks + i * QP + 4 * d4);
#pragma unroll
              for (int x = 0; x < 8; ++x) { const v4f kj = *(const LAS v4f*)(ks + (8 * jb + x) * QP + 4 * d4);
                  dk[x] += ki.x * kj.x + ki.y * kj.y + ki.z * kj.z + ki.w * kj.w; dq[x] += qi.x * kj.x + qi.y * kj.y + qi.z * kj.z + qi.w * kj.w; } }
#pragma unroll
          for (int x = 0; x < 8; ++x) { const int j = 8 * jb + x; const float dc = __expf(gi - gcs[j]); dk[x] = (j < i) ? bi * dk[x] * dc : 0.f; dq[x] = (j <= i) ? dq[x] * dc : 0.f; } }
      *(LAS v4f*)(Ls + i * 68 + 8 * jb) = (v4f){dk[0], dk[1], dk[2], dk[3]}; *(LAS v4f*)(Ls + i * 68 + 8 * jb + 4) = (v4f){dk[4], dk[5], dk[6], dk[7]};
      v4u w; w.x = pk2(dq[0], dq[1]); w.y = pk2(dq[2], dq[3]); w.z = pk2(dq[4], dq[5]); w.w = pk2(dq[6], dq[7]); *(v4u*)(GAT + i * 64 + 8 * jb) = w; }
    __syncthreads();
    if (tid < 256) {
        const int c = tid; int vz; asm volatile("v_mov_b32 %0, 0" : "=v"(vz));
        const LAS float* rp = (c < 128) ? (vs + c) : (ks + (c - 128)); const LAS float* mp = ((c < 128) ? bts : btg) + vz;
#define GDN_RHS(i) (rp[(i) * QP] * mp[(i)])
#define GDN_L4(i, j4) (*(const LAS v4f*)(Ls + (i) * 68 + 4 * (j4) + vz))
        float x0 = GDN_RHS(0); __builtin_amdgcn_sched_barrier(0);
        float x1 = GDN_RHS(1); { const v4f l = GDN_L4(1, 0); x1 -= l.x * x0; } __builtin_amdgcn_sched_barrier(0);
        float x2 = GDN_RHS(2); { const v4f l = GDN_L4(2, 0); x2 -= l.x * x0; x2 -= l.y * x1; } __builtin_amdgcn_sched_barrier(0);
        float x3 = GDN_RHS(3); { const v4f l = GDN_L4(3, 0); x3 -= l.x * x0; x3 -= l.y * x1; x3 -= l.z * x2; } __builtin_amdgcn_sched_barrier(0);
        float x4 = GDN_RHS(4); { const v4f l = GDN_L4(4, 0); x4 -= l.x * x0; x4 -= l.y * x1; x4 -= l.z * x2; x4 -= l.w * x3; } __builtin_amdgcn_sched_barrier(0);
        float x5 = GDN_RHS(5); { const v4f l = GDN_L4(5, 0); x5 -= l.x * x0; x5 -= l.y * x1; x5 -= l.z * x2; x5 -= l.w * x3; } { const v4f l = GDN_L4(5, 1); x5 -= l.x * x4; } __builtin_amdgcn_sched_barrier(0);
        float x6 = GDN_RHS(6); { const v4f l = GDN_L4(6, 0); x6 -= l.x * x0; x6 -= l.y * x1; x6 -= l.z * x2; x6 -= l.w * x3; } { const v4f l = GDN_L4(6, 1); x6 -= l.x * x4; x6 -= l.y * x5; } __builtin_amdgcn_sched_barrier(0);
        float x7 = GDN_RHS(7); { const v4f l = GDN_L4(7, 0); x7 -= l.x * x0; x7 -= l.y * x1; x7 -= l.z * x2; x7 -= l.w * x3; } { const v4f l = GDN_L4(7, 1); x7 -= l.x * x4; x7 -= l.y * x5; x7 -= l.z * x6; } __builtin_amdgcn_sched_barrier(0);
        float x8 = GDN_RHS(8); { const v4f l = GDN_L4(8, 0); x8 -= l.x * x0; x8 -= l.y * x1; x8 -= l.z * x2; x8 -= l.w * x3; } { const v4f l = GDN_L4(8, 1); x8 -= l.x * x4; x8 -= l.y * x5; x8 -= l.z * x6; x8 -= l.w * x7; } __builtin_amdgcn_sched_barrier(0);
        float x9 = GDN_RHS(9); { const v4f l = GDN_L4(9, 0); x9 -= l.x * x0; x9 -= l.y * x1; x9 -= l.z * x2; x9 -= l.w * x3; } { const v4f l = GDN_L4(9, 1); x9 -= l.x * x4; x9 -= l.y * x5; x9 -= l.z * x6; x9 -= l.w * x7; } { const v4f l = GDN_L4(9, 2); x9 -= l.x * x8; } __builtin_amdgcn_sched_barrier(0);
        float x10 = GDN_RHS(10); { const v4f l = GDN_L4(10, 0); x10 -= l.x * x0; x10 -= l.y * x1; x10 -= l.z * x2; x10 -= l.w * x3; } { const v4f l = GDN_L4(10, 1); x10 -= l.x * x4; x10 -= l.y * x5; x10 -= l.z * x6; x10 -= l.w * x7; } { const v4f l = GDN_L4(10, 2); x10 -= l.x * x8; x10 -= l.y * x9; } __builtin_amdgcn_sched_barrier(0);
        float x11 = GDN_RHS(11); { const v4f l = GDN_L4(11, 0); x11 -= l.x * x0; x11 -= l.y * x1; x11 -= l.z * x2; x11 -= l.w * x3; } { const v4f l = GDN_L4(11, 1); x11 -= l.x * x4; x11 -= l.y * x5; x11 -= l.z * x6; x11 -= l.w * x7; } { const v4f l = GDN_L4(11, 2); x11 -= l.x * x8; x11 -= l.y * x9; x11 -= l.z * x10; } __builtin_amdgcn_sched_barrier(0);
        float x12 = GDN_RHS(12); { const v4f l = GDN_L4(12, 0); x12 -= l.x * x0; x12 -= l.y * x1; x12 -= l.z * x2; x12 -= l.w * x3; } { const v4f l = GDN_L4(12, 1); x12 -= l.x * x4; x12 -= l.y * x5; x12 -= l.z * x6; x12 -= l.w * x7; } { const v4f l = GDN_L4(12, 2); x12 -= l.x * x8; x12 -= l.y * x9; x12 -= l.z * x10; x12 -= l.w * x11; } __builtin_amdgcn_sched_barrier(0);
        float x13 = GDN_RHS(13); { const v4f l = GDN_L4(13, 0); x13 -= l.x * x0; x13 -= l.y * x1; x13 -= l.z * x2; x13 -= l.w * x3; } { const v4f l = GDN_L4(13, 1); x13 -= l.x * x4; x13 -= l.y * x5; x13 -= l.z * x6; x13 -= l.w * x7; } { const v4f l = GDN_L4(13, 2); x13 -= l.x * x8; x13 -= l.y * x9; x13 -= l.z * x10; x13 -= l.w * x11; } { const v4f l = GDN_L4(13, 3); x13 -= l.x * x12; } __builtin_amdgcn_sched_barrier(0);
        float x14 = GDN_RHS(14); { const v4f l = GDN_L4(14, 0); x14 -= l.x * x0; x14 -= l.y * x1; x14 -= l.z * x2; x14 -= l.w * x3; } { const v4f l = GDN_L4(14, 1); x14 -= l.x * x4; x14 -= l.y * x5; x14 -= l.z * x6; x14 -= l.w * x7; } { const v4f l = GDN_L4(14, 2); x14 -= l.x * x8; x14 -= l.y * x9; x14 -= l.z * x10; x14 -= l.w * x11; } { const v4f l = GDN_L4(14, 3); x14 -= l.x * x12; x14 -= l.y * x13; } __builtin_amdgcn_sched_barrier(0);
        float x15 = GDN_RHS(15); { const v4f l = GDN_L4(15, 0); x15 -= l.x * x0; x15 -= l.y * x1; x15 -= l.z * x2; x15 -= l.w * x3; } { const v4f l = GDN_L4(15, 1); x15 -= l.x * x4; x15 -= l.y * x5; x15 -= l.z * x6; x15 -= l.w * x7; } { const v4f l = GDN_L4(15, 2); x15 -= l.x * x8; x15 -= l.y * x9; x15 -= l.z * x10; x15 -= l.w * x11; } { const v4f l = GDN_L4(15, 3); x15 -= l.x * x12; x15 -= l.y * x13; x15 -= l.z * x14; } __builtin_amdgcn_sched_barrier(0);
        float x16 = GDN_RHS(16); { const v4f l = GDN_L4(16, 0); x16 -= l.x * x0; x16 -= l.y * x1; x16 -= l.z * x2; x16 -= l.w * x3; } { const v4f l = GDN_L4(16, 1); x16 -= l.x * x4; x16 -= l.y * x5; x16 -= l.z * x6; x16 -= l.w * x7; } { const v4f l = GDN_L4(16, 2); x16 -= l.x * x8; x16 -= l.y * x9; x16 -= l.z * x10; x16 -= l.w * x11; } { const v4f l = GDN_L4(16, 3); x16 -= l.x * x12; x16 -= l.y * x13; x16 -= l.z * x14; x16 -= l.w * x15; } __builtin_amdgcn_sched_barrier(0);
        float x17 = GDN_RHS(17); { const v4f l = GDN_L4(17, 0); x17 -= l.x * x0; x17 -= l.y * x1; x17 -= l.z * x2; x17 -= l.w * x3; } { const v4f l = GDN_L4(17, 1); x17 -= l.x * x4; x17 -= l.y * x5; x17 -= l.z * x6; x17 -= l.w * x7; } { const v4f l = GDN_L4(17, 2); x17 -= l.x * x8; x17 -= l.y * x9; x17 -= l.z * x10; x17 -= l.w * x11; } { const v4f l = GDN_L4(17, 3); x17 -= l.x * x12; x17 -= l.y * x13; x17 -= l.z * x14; x17 -= l.w * x15; } { const v4f l = GDN_L4(17, 4); x17 -= l.x * x16; } __builtin_amdgcn_sched_barrier(0);
        float x18 = GDN_RHS(18); { const v4f l = GDN_L4(18, 0); x18 -= l.x * x0; x18 -= l.y * x1; x18 -= l.z * x2; x18 -= l.w * x3; } { const v4f l = GDN_L4(18, 1); x18 -= l.x * x4; x18 -= l.y * x5; x18 -= l.z * x6; x18 -= l.w * x7; } { const v4f l = GDN_L4(18, 2); x18 -= l.x * x8; x18 -= l.y * x9; x18 -= l.z * x10; x18 -= l.w * x11; } { const v4f l = GDN_L4(18, 3); x18 -= l.x * x12; x18 -= l.y * x13; x18 -= l.z * x14; x18 -= l.w * x15; } { const v4f l = GDN_L4(18, 4); x18 -= l.x * x16; x18 -= l.y * x17; } __builtin_amdgcn_sched_barrier(0);
        float x19 = GDN_RHS(19); { const v4f l = GDN_L4(19, 0); x19 -= l.x * x0; x19 -= l.y * x1; x19 -= l.z * x2; x19 -= l.w * x3; } { const v4f l = GDN_L4(19, 1); x19 -= l.x * x4; x19 -= l.y * x5; x19 -= l.z * x6; x19 -= l.w * x7; } { const v4f l = GDN_L4(19, 2); x19 -= l.x * x8; x19 -= l.y * x9; x19 -= l.z * x10; x19 -= l.w * x11; } { const v4f l = GDN_L4(19, 3); x19 -= l.x * x12; x19 -= l.y * x13; x19 -= l.z * x14; x19 -= l.w * x15; } { const v4f l = GDN_L4(19, 4); x19 -= l.x * x16; x19 -= l.y * x17; x19 -= l.z * x18; } __builtin_amdgcn_sched_barrier(0);
        float x20 = GDN_RHS(20); { const v4f l = GDN_L4(20, 0); x20 -= l.x * x0; x20 -= l.y * x1; x20 -= l.z * x2; x20 -= l.w * x3; } { const v4f l = GDN_L4(20, 1); x20 -= l.x * x4; x20 -= l.y * x5; x20 -= l.z * x6; x20 -= l.w * x7; } { const v4f l = GDN_L4(20, 2); x20 -= l.x * x8; x20 -= l.y * x9; x20 -= l.z * x10; x20 -= l.w * x11; } { const v4f l = GDN_L4(20, 3); x20 -= l.x * x12; x20 -= l.y * x13; x20 -= l.z * x14; x20 -= l.w * x15; } { const v4f l = GDN_L4(20, 4); x20 -= l.x * x16; x20 -= l.y * x17; x20 -= l.z * x18; x20 -= l.w * x19; } __builtin_amdgcn_sched_barrier(0);
        float x21 = GDN_RHS(21); { const v4f l = GDN_L4(21, 0); x21 -= l.x * x0; x21 -= l.y * x1; x21 -= l.z * x2; x21 -= l.w * x3; } { const v4f l = GDN_L4(21, 1); x21 -= l.x * x4; x21 -= l.y * x5; x21 -= l.z * x6; x21 -= l.w * x7; } { const v4f l = GDN_L4(21, 2); x21 -= l.x * x8; x21 -= l.y * x9; x21 -= l.z * x10; x21 -= l.w * x11; } { const v4f l = GDN_L4(21, 3); x21 -= l.x * x12; x21 -= l.y * x13; x21 -= l.z * x14; x21 -= l.w * x15; } { const v4f l = GDN_L4(21, 4); x21 -= l.x * x16; x21 -= l.y * x17; x21 -= l.z * x18; x21 -= l.w * x19; } { const v4f l = GDN_L4(21, 5); x21 -= l.x * x20; } __builtin_amdgcn_sched_barrier(0);
        float x22 = GDN_RHS(22); { const v4f l = GDN_L4(22, 0); x22 -= l.x * x0; x22 -= l.y * x1; x22 -= l.z * x2; x22 -= l.w * x3; } { const v4f l = GDN_L4(22, 1); x22 -= l.x * x4; x22 -= l.y * x5; x22 -= l.z * x6; x22 -= l.w * x7; } { const v4f l = GDN_L4(22, 2); x22 -= l.x * x8; x22 -= l.y * x9; x22 -= l.z * x10; x22 -= l.w * x11; } { const v4f l = GDN_L4(22, 3); x22 -= l.x * x12; x22 -= l.y * x13; x22 -= l.z * x14; x22 -= l.w * x15; } { const v4f l = GDN_L4(22, 4); x22 -= l.x * x16; x22 -= l.y * x17; x22 -= l.z * x18; x22 -= l.w * x19; } { const v4f l = GDN_L4(22, 5); x22 -= l.x * x20; x22 -= l.y * x21; } __builtin_amdgcn_sched_barrier(0);
        float x23 = GDN_RHS(23); { const v4f l = GDN_L4(23, 0); x23 -= l.x * x0; x23 -= l.y * x1; x23 -= l.z * x2; x23 -= l.w * x3; } { const v4f l = GDN_L4(23, 1); x23 -= l.x * x4; x23 -= l.y * x5; x23 -= l.z * x6; x23 -= l.w * x7; } { const v4f l = GDN_L4(23, 2); x23 -= l.x * x8; x23 -= l.y * x9; x23 -= l.z * x10; x23 -= l.w * x11; } { const v4f l = GDN_L4(23, 3); x23 -= l.x * x12; x23 -= l.y * x13; x23 -= l.z * x14; x23 -= l.w * x15; } { const v4f l = GDN_L4(23, 4); x23 -= l.x * x16; x23 -= l.y * x17; x23 -= l.z * x18; x23 -= l.w * x19; } { const v4f l = GDN_L4(23, 5); x23 -= l.x * x20; x23 -= l.y * x21; x23 -= l.z * x22; } __builtin_amdgcn_sched_barrier(0);
        float x24 = GDN_RHS(24); { const v4f l = GDN_L4(24, 0); x24 -= l.x * x0; x24 -= l.y * x1; x24 -= l.z * x2; x24 -= l.w * x3; } { const v4f l = GDN_L4(24, 1); x24 -= l.x * x4; x24 -= l.y * x5; x24 -= l.z * x6; x24 -= l.w * x7; } { const v4f l = GDN_L4(24, 2); x24 -= l.x * x8; x24 -= l.y * x9; x24 -= l.z * x10; x24 -= l.w * x11; } { const v4f l = GDN_L4(24, 3); x24 -= l.x * x12; x24 -= l.y * x13; x24 -= l.z * x14; x24 -= l.w * x15; } { const v4f l = GDN_L4(24, 4); x24 -= l.x * x16; x24 -= l.y * x17; x24 -= l.z * x18; x24 -= l.w * x19; } { const v4f l = GDN_L4(24, 5); x24 -= l.x * x20; x24 -= l.y * x21; x24 -= l.z * x22; x24 -= l.w * x23; } __builtin_amdgcn_sched_barrier(0);
        float x25 = GDN_RHS(25); { const v4f l = GDN_L4(25, 0); x25 -= l.x * x0; x25 -= l.y * x1; x25 -= l.z * x2; x25 -= l.w * x3; } { const v4f l = GDN_L4(25, 1); x25 -= l.x * x4; x25 -= l.y * x5; x25 -= l.z * x6; x25 -= l.w * x7; } { const v4f l = GDN_L4(25, 2); x25 -= l.x * x8; x25 -= l.y * x9; x25 -= l.z * x10; x25 -= l.w * x11; } { const v4f l = GDN_L4(25, 3); x25 -= l.x * x12; x25 -= l.y * x13; x25 -= l.z * x14; x25 -= l.w * x15; } { const v4f l = GDN_L4(25, 4); x25 -= l.x * x16; x25 -= l.y * x17; x25 -= l.z * x18; x25 -= l.w * x19; } { const v4f l = GDN_L4(25, 5); x25 -= l.x * x20; x25 -= l.y * x21; x25 -= l.z * x22; x25 -= l.w * x23; } { const v4f l = GDN_L4(25, 6); x25 -= l.x * x24; } __builtin_amdgcn_sched_barrier(0);
        float x26 = GDN_RHS(26); { const v4f l = GDN_L4(26, 0); x26 -= l.x * x0; x26 -= l.y * x1; x26 -= l.z * x2; x26 -= l.w * x3; } { const v4f l = GDN_L4(26, 1); x26 -= l.x * x4; x26 -= l.y * x5; x26 -= l.z * x6; x26 -= l.w * x7; } { const v4f l = GDN_L4(26, 2); x26 -= l.x * x8; x26 -= l.y * x9; x26 -= l.z * x10; x26 -= l.w * x11; } { const v4f l = GDN_L4(26, 3); x26 -= l.x * x12; x26 -= l.y * x13; x26 -= l.z * x14; x26 -= l.w * x15; } { const v4f l = GDN_L4(26, 4); x26 -= l.x * x16; x26 -= l.y * x17; x26 -= l.z * x18; x26 -= l.w * x19; } { const v4f l = GDN_L4(26, 5); x26 -= l.x * x20; x26 -= l.y * x21; x26 -= l.z * x22; x26 -= l.w * x23; } { const v4f l = GDN_L4(26, 6); x26 -= l.x * x24; x26 -= l.y * x25; } __builtin_amdgcn_sched_barrier(0);
        float x27 = GDN_RHS(27); { const v4f l = GDN_L4(27, 0); x27 -= l.x * x0; x27 -= l.y * x1; x27 -= l.z * x2; x27 -= l.w * x3; } { const v4f l = GDN_L4(27, 1); x27 -= l.x * x4; x27 -= l.y * x5; x27 -= l.z * x6; x27 -= l.w * x7; } { const v4f l = GDN_L4(27, 2); x27 -= l.x * x8; x27 -= l.y * x9; x27 -= l.z * x10; x27 -= l.w * x11; } { const v4f l = GDN_L4(27, 3); x27 -= l.x * x12; x27 -= l.y * x13; x27 -= l.z * x14; x27 -= l.w * x15; } { const v4f l = GDN_L4(27, 4); x27 -= l.x * x16; x27 -= l.y * x17; x27 -= l.z * x18; x27 -= l.w * x19; } { const v4f l = GDN_L4(27, 5); x27 -= l.x * x20; x27 -= l.y * x21; x27 -= l.z * x22; x27 -= l.w * x23; } { const v4f l = GDN_L4(27, 6); x27 -= l.x * x24; x27 -= l.y * x25; x27 -= l.z * x26; } __builtin_amdgcn_sched_barrier(0);
        float x28 = GDN_RHS(28); { const v4f l = GDN_L4(28, 0); x28 -= l.x * x0; x28 -= l.y * x1; x28 -= l.z * x2; x28 -= l.w * x3; } { const v4f l = GDN_L4(28, 1); x28 -= l.x * x4; x28 -= l.y * x5; x28 -= l.z * x6; x28 -= l.w * x7; } { const v4f l = GDN_L4(28, 2); x28 -= l.x * x8; x28 -= l.y * x9; x28 -= l.z * x10; x28 -= l.w * x11; } { const v4f l = GDN_L4(28, 3); x28 -= l.x * x12; x28 -= l.y * x13; x28 -= l.z * x14; x28 -= l.w * x15; } { const v4f l = GDN_L4(28, 4); x28 -= l.x * x16; x28 -= l.y * x17; x28 -= l.z * x18; x28 -= l.w * x19; } { const v4f l = GDN_L4(28, 5); x28 -= l.x * x20; x28 -= l.y * x21; x28 -= l.z * x22; x28 -= l.w * x23; } { const v4f l = GDN_L4(28, 6); x28 -= l.x * x24; x28 -= l.y * x25; x28 -= l.z * x26; x28 -= l.w * x27; } __builtin_amdgcn_sched_barrier(0);
        float x29 = GDN_RHS(29); { const v4f l = GDN_L4(29, 0); x29 -= l.x * x0; x29 -= l.y * x1; x29 -= l.z * x2; x29 -= l.w * x3; } { const v4f l = GDN_L4(29, 1); x29 -= l.x * x4; x29 -= l.y * x5; x29 -= l.z * x6; x29 -= l.w * x7; } { const v4f l = GDN_L4(29, 2); x29 -= l.x * x8; x29 -= l.y * x9; x29 -= l.z * x10; x29 -= l.w * x11; } { const v4f l = GDN_L4(29, 3); x29 -= l.x * x12; x29 -= l.y * x13; x29 -= l.z * x14; x29 -= l.w * x15; } { const v4f l = GDN_L4(29, 4); x29 -= l.x * x16; x29 -= l.y * x17; x29 -= l.z * x18; x29 -= l.w * x19; } { const v4f l = GDN_L4(29, 5); x29 -= l.x * x20; x29 -= l.y * x21; x29 -= l.z * x22; x29 -= l.w * x23; } { const v4f l = GDN_L4(29, 6); x29 -= l.x * x24; x29 -= l.y * x25; x29 -= l.z * x26; x29 -= l.w * x27; } { const v4f l = GDN_L4(29, 7); x29 -= l.x * x28; } __builtin_amdgcn_sched_barrier(0);
        float x30 = GDN_RHS(30); { const v4f l = GDN_L4(30, 0); x30 -= l.x * x0; x30 -= l.y * x1; x30 -= l.z * x2; x30 -= l.w * x3; } { const v4f l = GDN_L4(30, 1); x30 -= l.x * x4; x30 -= l.y * x5; x30 -= l.z * x6; x30 -= l.w * x7; } { const v4f l = GDN_L4(30, 2); x30 -= l.x * x8; x30 -= l.y * x9; x30 -= l.z * x10; x30 -= l.w * x11; } { const v4f l = GDN_L4(30, 3); x30 -= l.x * x12; x30 -= l.y * x13; x30 -= l.z * x14; x30 -= l.w * x15; } { const v4f l = GDN_L4(30, 4); x30 -= l.x * x16; x30 -= l.y * x17; x30 -= l.z * x18; x30 -= l.w * x19; } { const v4f l = GDN_L4(30, 5); x30 -= l.x * x20; x30 -= l.y * x21; x30 -= l.z * x22; x30 -= l.w * x23; } { const v4f l = GDN_L4(30, 6); x30 -= l.x * x24; x30 -= l.y * x25; x30 -= l.z * x26; x30 -= l.w * x27; } { const v4f l = GDN_L4(30, 7); x30 -= l.x * x28; x30 -= l.y * x29; } __builtin_amdgcn_sched_barrier(0);
        float x31 = GDN_RHS(31); { const v4f l = GDN_L4(31, 0); x31 -= l.x * x0; x31 -= l.y * x1; x31 -= l.z * x2; x31 -= l.w * x3; } { const v4f l = GDN_L4(31, 1); x31 -= l.x * x4; x31 -= l.y * x5; x31 -= l.z * x6; x31 -= l.w * x7; } { const v4f l = GDN_L4(31, 2); x31 -= l.x * x8; x31 -= l.y * x9; x31 -= l.z * x10; x31 -= l.w * x11; } { const v4f l = GDN_L4(31, 3); x31 -= l.x * x12; x31 -= l.y * x13; x31 -= l.z * x14; x31 -= l.w * x15; } { const v4f l = GDN_L4(31, 4); x31 -= l.x * x16; x31 -= l.y * x17; x31 -= l.z * x18; x31 -= l.w * x19; } { const v4f l = GDN_L4(31, 5); x31 -= l.x * x20; x31 -= l.y * x21; x31 -= l.z * x22; x31 -= l.w * x23; } { const v4f l = GDN_L4(31, 6); x31 -= l.x * x24; x31 -= l.y * x25; x31 -= l.z * x26; x31 -= l.w * x27; } { const v4f l = GDN_L4(31, 7); x31 -= l.x * x28; x31 -= l.y * x29; x31 -= l.z * x30; } __builtin_amdgcn_sched_barrier(0);
        float x32 = GDN_RHS(32); { const v4f l = GDN_L4(32, 0); x32 -= l.x * x0; x32 -= l.y * x1; x32 -= l.z * x2; x32 -= l.w * x3; } { const v4f l = GDN_L4(32, 1); x32 -= l.x * x4; x32 -= l.y * x5; x32 -= l.z * x6; x32 -= l.w * x7; } { const v4f l = GDN_L4(32, 2); x32 -= l.x * x8; x32 -= l.y * x9; x32 -= l.z * x10; x32 -= l.w * x11; } { const v4f l = GDN_L4(32, 3); x32 -= l.x * x12; x32 -= l.y * x13; x32 -= l.z * x14; x32 -= l.w * x15; } { const v4f l = GDN_L4(32, 4); x32 -= l.x * x16; x32 -= l.y * x17; x32 -= l.z * x18; x32 -= l.w * x19; } { const v4f l = GDN_L4(32, 5); x32 -= l.x * x20; x32 -= l.y * x21; x32 -= l.z * x22; x32 -= l.w * x23; } { const v4f l = GDN_L4(32, 6); x32 -= l.x * x24; x32 -= l.y * x25; x32 -= l.z * x26; x32 -= l.w * x27; } { const v4f l = GDN_L4(32, 7); x32 -= l.x * x28; x32 -= l.y * x29; x32 -= l.z * x30; x32 -= l.w * x31; } __builtin_amdgcn_sched_barrier(0);
        float x33 = GDN_RHS(33); { const v4f l = GDN_L4(33, 0); x33 -= l.x * x0; x33 -= l.y * x1; x33 -= l.z * x2; x33 -= l.w * x3; } { const v4f l = GDN_L4(33, 1); x33 -= l.x * x4; x33 -= l.y * x5; x33 -= l.z * x6; x33 -= l.w * x7; } { const v4f l = GDN_L4(33, 2); x33 -= l.x * x8; x33 -= l.y * x9; x33 -= l.z * x10; x33 -= l.w * x11; } { const v4f l = GDN_L4(33, 3); x33 -= l.x * x12; x33 -= l.y * x13; x33 -= l.z * x14; x33 -= l.w * x15; } { const v4f l = GDN_L4(33, 4); x33 -= l.x * x16; x33 -= l.y * x17; x33 -= l.z * x18; x33 -= l.w * x19; } { const v4f l = GDN_L4(33, 5); x33 -= l.x * x20; x33 -= l.y * x21; x33 -= l.z * x22; x33 -= l.w * x23; } { const v4f l = GDN_L4(33, 6); x33 -= l.x * x24; x33 -= l.y * x25; x33 -= l.z * x26; x33 -= l.w * x27; } { const v4f l = GDN_L4(33, 7); x33 -= l.x * x28; x33 -= l.y * x29; x33 -= l.z * x30; x33 -= l.w * x31; } { const v4f l = GDN_L4(33, 8); x33 -= l.x * x32; } __builtin_amdgcn_sched_barrier(0);
        float x34 = GDN_RHS(34); { const v4f l = GDN_L4(34, 0); x34 -= l.x * x0; x34 -= l.y * x1; x34 -= l.z * x2; x34 -= l.w * x3; } { const v4f l = GDN_L4(34, 1); x34 -= l.x * x4; x34 -= l.y * x5; x34 -= l.z * x6; x34 -= l.w * x7; } { const v4f l = GDN_L4(34, 2); x34 -= l.x * x8; x34 -= l.y * x9; x34 -= l.z * x10; x34 -= l.w * x11; } { const v4f l = GDN_L4(34, 3); x34 -= l.x * x12; x34 -= l.y * x13; x34 -= l.z * x14; x34 -= l.w * x15; } { const v4f l = GDN_L4(34, 4); x34 -= l.x * x16; x34 -= l.y * x17; x34 -= l.z * x18; x34 -= l.w * x19; } { const v4f l = GDN_L4(34, 5); x34 -= l.x * x20; x34 -= l.y * x21; x34 -= l.z * x22; x34 -= l.w * x23; } { const v4f l = GDN_L4(34, 6); x34 -= l.x * x24; x34 -= l.y * x25; x34 -= l.z * x26; x34 -= l.w * x27; } { const v4f l = GDN_L4(34, 7); x34 -= l.x * x28; x34 -= l.y * x29; x34 -= l.z * x30; x34 -= l.w * x31; } { const v4f l = GDN_L4(34, 8); x34 -= l.x * x32; x34 -= l.y * x33; } __builtin_amdgcn_sched_barrier(0);
        float x35 = GDN_RHS(35); { const v4f l = GDN_L4(35, 0); x35 -= l.x * x0; x35 -= l.y * x1; x35 -= l.z * x2; x35 -= l.w * x3; } { const v4f l = GDN_L4(35, 1); x35 -= l.x * x4; x35 -= l.y * x5; x35 -= l.z * x6; x35 -= l.w * x7; } { const v4f l = GDN_L4(35, 2); x35 -= l.x * x8; x35 -= l.y * x9; x35 -= l.z * x10; x35 -= l.w * x11; } { const v4f l = GDN_L4(35, 3); x35 -= l.x * x12; x35 -= l.y * x13; x35 -= l.z * x14; x35 -= l.w * x15; } { const v4f l = GDN_L4(35, 4); x35 -= l.x * x16; x35 -= l.y * x17; x35 -= l.z * x18; x35 -= l.w * x19; } { const v4f l = GDN_L4(35, 5); x35 -= l.x * x20; x35 -= l.y * x21; x35 -= l.z * x22; x35 -= l.w * x23; } { const v4f l = GDN_L4(35, 6); x35 -= l.x * x24; x35 -= l.y * x25; x35 -= l.z * x26; x35 -= l.w * x27; } { const v4f l = GDN_L4(35, 7); x35 -= l.x * x28; x35 -= l.y * x29; x35 -= l.z * x30; x35 -= l.w * x31; } { const v4f l = GDN_L4(35, 8); x35 -= l.x * x32; x35 -= l.y * x33; x35 -= l.z * x34; } __builtin_amdgcn_sched_barrier(0);
        float x36 = GDN_RHS(36); { const v4f l = GDN_L4(36, 0); x36 -= l.x * x0; x36 -= l.y * x1; x36 -= l.z * x2; x36 -= l.w * x3; } { const v4f l = GDN_L4(36, 1); x36 -= l.x * x4; x36 -= l.y * x5; x36 -= l.z * x6; x36 -= l.w * x7; } { const v4f l = GDN_L4(36, 2); x36 -= l.x * x8; x36 -= l.y * x9; x36 -= l.z * x10; x36 -= l.w * x11; } { const v4f l = GDN_L4(36, 3); x36 -= l.x * x12; x36 -= l.y * x13; x36 -= l.z * x14; x36 -= l.w * x15; } { const v4f l = GDN_L4(36, 4); x36 -= l.x * x16; x36 -= l.y * x17; x36 -= l.z * x18; x36 -= l.w * x19; } { const v4f l = GDN_L4(36, 5); x36 -= l.x * x20; x36 -= l.y * x21; x36 -= l.z * x22; x36 -= l.w * x23; } { const v4f l = GDN_L4(36, 6); x36 -= l.x * x24; x36 -= l.y * x25; x36 -= l.z * x26; x36 -= l.w * x27; } { const v4f l = GDN_L4(36, 7); x36 -= l.x * x28; x36 -= l.y * x29; x36 -= l.z * x30; x36 -= l.w * x31; } { const v4f l = GDN_L4(36, 8); x36 -= l.x * x32; x36 -= l.y * x33; x36 -= l.z * x34; x36 -= l.w * x35; } __builtin_amdgcn_sched_barrier(0);
        float x37 = GDN_RHS(37); { const v4f l = GDN_L4(37, 0); x37 -= l.x * x0; x37 -= l.y * x1; x37 -= l.z * x2; x37 -= l.w * x3; } { const v4f l = GDN_L4(37, 1); x37 -= l.x * x4; x37 -= l.y * x5; x37 -= l.z * x6; x37 -= l.w * x7; } { const v4f l = GDN_L4(37, 2); x37 -= l.x * x8; x37 -= l.y * x9; x37 -= l.z * x10; x37 -= l.w * x11; } { const v4f l = GDN_L4(37, 3); x37 -= l.x * x12; x37 -= l.y * x13; x37 -= l.z * x14; x37 -= l.w * x15; } { const v4f l = GDN_L4(37, 4); x37 -= l.x * x16; x37 -= l.y * x17; x37 -= l.z * x18; x37 -= l.w * x19; } { const v4f l = GDN_L4(37, 5); x37 -= l.x * x20; x37 -= l.y * x21; x37 -= l.z * x22; x37 -= l.w * x23; } { const v4f l = GDN_L4(37, 6); x37 -= l.x * x24; x37 -= l.y * x25; x37 -= l.z * x26; x37 -= l.w * x27; } { const v4f l = GDN_L4(37, 7); x37 -= l.x * x28; x37 -= l.y * x29; x37 -= l.z * x30; x37 -= l.w * x31; } { const v4f l = GDN_L4(37, 8); x37 -= l.x * x32; x37 -= l.y * x33; x37 -= l.z * x34; x37 -= l.w * x35; } { const v4f l = GDN_L4(37, 9); x37 -= l.x * x36; } __builtin_amdgcn_sched_barrier(0);
        float x38 = GDN_RHS(38); { const v4f l = GDN_L4(38, 0); x38 -= l.x * x0; x38 -= l.y * x1; x38 -= l.z * x2; x38 -= l.w * x3; } { const v4f l = GDN_L4(38, 1); x38 -= l.x * x4; x38 -= l.y * x5; x38 -= l.z * x6; x38 -= l.w * x7; } { const v4f l = GDN_L4(38, 2); x38 -= l.x * x8; x38 -= l.y * x9; x38 -= l.z * x10; x38 -= l.w * x11; } { const v4f l = GDN_L4(38, 3); x38 -= l.x * x12; x38 -= l.y * x13; x38 -= l.z * x14; x38 -= l.w * x15; } { const v4f l = GDN_L4(38, 4); x38 -= l.x * x16; x38 -= l.y * x17; x38 -= l.z * x18; x38 -= l.w * x19; } { const v4f l = GDN_L4(38, 5); x38 -= l.x * x20; x38 -= l.y * x21; x38 -= l.z * x22; x38 -= l.w * x23; } { const v4f l = GDN_L4(38, 6); x38 -= l.x * x24; x38 -= l.y * x25; x38 -= l.z * x26; x38 -= l.w * x27; } { const v4f l = GDN_L4(38, 7); x38 -= l.x * x28; x38 -= l.y * x29; x38 -= l.z * x30; x38 -= l.w * x31; } { const v4f l = GDN_L4(38, 8); x38 -= l.x * x32; x38 -= l.y * x33; x38 -= l.z * x34; x38 -= l.w * x35; } { const v4f l = GDN_L4(38, 9); x38 -= l.x * x36; x38 -= l.y * x37; } __builtin_amdgcn_sched_barrier(0);
        float x39 = GDN_RHS(39); { const v4f l = GDN_L4(39, 0); x39 -= l.x * x0; x39 -= l.y * x1; x39 -= l.z * x2; x39 -= l.w * x3; } { const v4f l = GDN_L4(39, 1); x39 -= l.x * x4; x39 -= l.y * x5; x39 -= l.z * x6; x39 -= l.w * x7; } { const v4f l = GDN_L4(39, 2); x39 -= l.x * x8; x39 -= l.y * x9; x39 -= l.z * x10; x39 -= l.w * x11; } { const v4f l = GDN_L4(39, 3); x39 -= l.x * x12; x39 -= l.y * x13; x39 -= l.z * x14; x39 -= l.w * x15; } { const v4f l = GDN_L4(39, 4); x39 -= l.x * x16; x39 -= l.y * x17; x39 -= l.z * x18; x39 -= l.w * x19; } { const v4f l = GDN_L4(39, 5); x39 -= l.x * x20; x39 -= l.y * x21; x39 -= l.z * x22; x39 -= l.w * x23; } { const v4f l = GDN_L4(39, 6); x39 -= l.x * x24; x39 -= l.y * x25; x39 -= l.z * x26; x39 -= l.w * x27; } { const v4f l = GDN_L4(39, 7); x39 -= l.x * x28; x39 -= l.y * x29; x39 -= l.z * x30; x39 -= l.w * x31; } { const v4f l = GDN_L4(39, 8); x39 -= l.x * x32; x39 -= l.y * x33; x39 -= l.z * x34; x39 -= l.w * x35; } { const v4f l = GDN_L4(39, 9); x39 -= l.x * x36; x39 -= l.y * x37; x39 -= l.z * x38; } __builtin_amdgcn_sched_barrier(0);
        float x40 = GDN_RHS(40); { const v4f l = GDN_L4(40, 0); x40 -= l.x * x0; x40 -= l.y * x1; x40 -= l.z * x2; x40 -= l.w * x3; } { const v4f l = GDN_L4(40, 1); x40 -= l.x * x4; x40 -= l.y * x5; x40 -= l.z * x6; x40 -= l.w * x7; } { const v4f l = GDN_L4(40, 2); x40 -= l.x * x8; x40 -= l.y * x9; x40 -= l.z * x10; x40 -= l.w * x11; } { const v4f l = GDN_L4(40, 3); x40 -= l.x * x12; x40 -= l.y * x13; x40 -= l.z * x14; x40 -= l.w * x15; } { const v4f l = GDN_L4(40, 4); x40 -= l.x * x16; x40 -= l.y * x17; x40 -= l.z * x18; x40 -= l.w * x19; } { const v4f l = GDN_L4(40, 5); x40 -= l.x * x20; x40 -= l.y * x21; x40 -= l.z * x22; x40 -= l.w * x23; } { const v4f l = GDN_L4(40, 6); x40 -= l.x * x24; x40 -= l.y * x25; x40 -= l.z * x26; x40 -= l.w * x27; } { const v4f l = GDN_L4(40, 7); x40 -= l.x * x28; x40 -= l.y * x29; x40 -= l.z * x30; x40 -= l.w * x31; } { const v4f l = GDN_L4(40, 8); x40 -= l.x * x32; x40 -= l.y * x33; x40 -= l.z * x34; x40 -= l.w * x35; } { const v4f l = GDN_L4(40, 9); x40 -= l.x * x36; x40 -= l.y * x37; x40 -= l.z * x38; x40 -= l.w * x39; } __builtin_amdgcn_sched_barrier(0);
        float x41 = GDN_RHS(41); { const v4f l = GDN_L4(41, 0); x41 -= l.x * x0; x41 -= l.y * x1; x41 -= l.z * x2; x41 -= l.w * x3; } { const v4f l = GDN_L4(41, 1); x41 -= l.x * x4; x41 -= l.y * x5; x41 -= l.z * x6; x41 -= l.w * x7; } { const v4f l = GDN_L4(41, 2); x41 -= l.x * x8; x41 -= l.y * x9; x41 -= l.z * x10; x41 -= l.w * x11; } { const v4f l = GDN_L4(41, 3); x41 -= l.x * x12; x41 -= l.y * x13; x41 -= l.z * x14; x41 -= l.w * x15; } { const v4f l = GDN_L4(41, 4); x41 -= l.x * x16; x41 -= l.y * x17; x41 -= l.z * x18; x41 -= l.w * x19; } { const v4f l = GDN_L4(41, 5); x41 -= l.x * x20; x41 -= l.y * x21; x41 -= l.z * x22; x41 -= l.w * x23; } { const v4f l = GDN_L4(41, 6); x41 -= l.x * x24; x41 -= l.y * x25; x41 -= l.z * x26; x41 -= l.w * x27; } { const v4f l = GDN_L4(41, 7); x41 -= l.x * x28; x41 -= l.y * x29; x41 -= l.z * x30; x41 -= l.w * x31; } { const v4f l = GDN_L4(41, 8); x41 -= l.x * x32; x41 -= l.y * x33; x41 -= l.z * x34; x41 -= l.w * x35; } { const v4f l = GDN_L4(41, 9); x41 -= l.x * x36; x41 -= l.y * x37; x41 -= l.z * x38; x41 -= l.w * x39; } { const v4f l = GDN_L4(41, 10); x41 -= l.x * x40; } __builtin_amdgcn_sched_barrier(0);
        float x42 = GDN_RHS(42); { const v4f l = GDN_L4(42, 0); x42 -= l.x * x0; x42 -= l.y * x1; x42 -= l.z * x2; x42 -= l.w * x3; } { const v4f l = GDN_L4(42, 1); x42 -= l.x * x4; x42 -= l.y * x5; x42 -= l.z * x6; x42 -= l.w * x7; } { const v4f l = GDN_L4(42, 2); x42 -= l.x * x8; x42 -= l.y * x9; x42 -= l.z * x10; x42 -= l.w * x11; } { const v4f l = GDN_L4(42, 3); x42 -= l.x * x12; x42 -= l.y * x13; x42 -= l.z * x14; x42 -= l.w * x15; } { const v4f l = GDN_L4(42, 4); x42 -= l.x * x16; x42 -= l.y * x17; x42 -= l.z * x18; x42 -= l.w * x19; } { const v4f l = GDN_L4(42, 5); x42 -= l.x * x20; x42 -= l.y * x21; x42 -= l.z * x22; x42 -= l.w * x23; } { const v4f l = GDN_L4(42, 6); x42 -= l.x * x24; x42 -= l.y * x25; x42 -= l.z * x26; x42 -= l.w * x27; } { const v4f l = GDN_L4(42, 7); x42 -= l.x * x28; x42 -= l.y * x29; x42 -= l.z * x30; x42 -= l.w * x31; } { const v4f l = GDN_L4(42, 8); x42 -= l.x * x32; x42 -= l.y * x33; x42 -= l.z * x34; x42 -= l.w * x35; } { const v4f l = GDN_L4(42, 9); x42 -= l.x * x36; x42 -= l.y * x37; x42 -= l.z * x38; x42 -= l.w * x39; } { const v4f l = GDN_L4(42, 10); x42 -= l.x * x40; x42 -= l.y * x41; } __builtin_amdgcn_sched_barrier(0);
        float x43 = GDN_RHS(43); { const v4f l = GDN_L4(43, 0); x43 -= l.x * x0; x43 -= l.y * x1; x43 -= l.z * x2; x43 -= l.w * x3; } { const v4f l = GDN_L4(43, 1); x43 -= l.x * x4; x43 -= l.y * x5; x43 -= l.z * x6; x43 -= l.w * x7; } { const v4f l = GDN_L4(43, 2); x43 -= l.x * x8; x43 -= l.y * x9; x43 -= l.z * x10; x43 -= l.w * x11; } { const v4f l = GDN_L4(43, 3); x43 -= l.x * x12; x43 -= l.y * x13; x43 -= l.z * x14; x43 -= l.w * x15; } { const v4f l = GDN_L4(43, 4); x43 -= l.x * x16; x43 -= l.y * x17; x43 -= l.z * x18; x43 -= l.w * x19; } { const v4f l = GDN_L4(43, 5); x43 -= l.x * x20; x43 -= l.y * x21; x43 -= l.z * x22; x43 -= l.w * x23; } { const v4f l = GDN_L4(43, 6); x43 -= l.x * x24; x43 -= l.y * x25; x43 -= l.z * x26; x43 -= l.w * x27; } { const v4f l = GDN_L4(43, 7); x43 -= l.x * x28; x43 -= l.y * x29; x43 -= l.z * x30; x43 -= l.w * x31; } { const v4f l = GDN_L4(43, 8); x43 -= l.x * x32; x43 -= l.y * x33; x43 -= l.z * x34; x43 -= l.w * x35; } { const v4f l = GDN_L4(43, 9); x43 -= l.x * x36; x43 -= l.y * x37; x43 -= l.z * x38; x43 -= l.w * x39; } { const v4f l = GDN_L4(43, 10); x43 -= l.x * x40; x43 -= l.y * x41; x43 -= l.z * x42; } __builtin_amdgcn_sched_barrier(0);
        float x44 = GDN_RHS(44); { const v4f l = GDN_L4(44, 0); x44 -= l.x * x0; x44 -= l.y * x1; x44 -= l.z * x2; x44 -= l.w * x3; } { const v4f l = GDN_L4(44, 1); x44 -= l.x * x4; x44 -= l.y * x5; x44 -= l.z * x6; x44 -= l.w * x7; } { const v4f l = GDN_L4(44, 2); x44 -= l.x * x8; x44 -= l.y * x9; x44 -= l.z * x10; x44 -= l.w * x11; } { const v4f l = GDN_L4(44, 3); x44 -= l.x * x12; x44 -= l.y * x13; x44 -= l.z * x14; x44 -= l.w * x15; } { const v4f l = GDN_L4(44, 4); x44 -= l.x * x16; x44 -= l.y * x17; x44 -= l.z * x18; x44 -= l.w * x19; } { const v4f l = GDN_L4(44, 5); x44 -= l.x * x20; x44 -= l.y * x21; x44 -= l.z * x22; x44 -= l.w * x23; } { const v4f l = GDN_L4(44, 6); x44 -= l.x * x24; x44 -= l.y * x25; x44 -= l.z * x26; x44 -= l.w * x27; } { const v4f l = GDN_L4(44, 7); x44 -= l.x * x28; x44 -= l.y * x29; x44 -= l.z * x30; x44 -= l.w * x31; } { const v4f l = GDN_L4(44, 8); x44 -= l.x * x32; x44 -= l.y * x33; x44 -= l.z * x34; x44 -= l.w * x35; } { const v4f l = GDN_L4(44, 9); x44 -= l.x * x36; x44 -= l.y * x37; x44 -= l.z * x38; x44 -= l.w * x39; } { const v4f l = GDN_L4(44, 10); x44 -= l.x * x40; x44 -= l.y * x41; x44 -= l.z * x42; x44 -= l.w * x43; } __builtin_amdgcn_sched_barrier(0);
        float x45 = GDN_RHS(45); { const v4f l = GDN_L4(45, 0); x45 -= l.x * x0; x45 -= l.y * x1; x45 -= l.z * x2; x45 -= l.w * x3; } { const v4f l = GDN_L4(45, 1); x45 -= l.x * x4; x45 -= l.y * x5; x45 -= l.z * x6; x45 -= l.w * x7; } { const v4f l = GDN_L4(45, 2); x45 -= l.x * x8; x45 -= l.y * x9; x45 -= l.z * x10; x45 -= l.w * x11; } { const v4f l = GDN_L4(45, 3); x45 -= l.x * x12; x45 -= l.y * x13; x45 -= l.z * x14; x45 -= l.w * x15; } { const v4f l = GDN_L4(45, 4); x45 -= l.x * x16; x45 -= l.y * x17; x45 -= l.z * x18; x45 -= l.w * x19; } { const v4f l = GDN_L4(45, 5); x45 -= l.x * x20; x45 -= l.y * x21; x45 -= l.z * x22; x45 -= l.w * x23; } { const v4f l = GDN_L4(45, 6); x45 -= l.x * x24; x45 -= l.y * x25; x45 -= l.z * x26; x45 -= l.w * x27; } { const v4f l = GDN_L4(45, 7); x45 -= l.x * x28; x45 -= l.y * x29; x45 -= l.z * x30; x45 -= l.w * x31; } { const v4f l = GDN_L4(45, 8); x45 -= l.x * x32; x45 -= l.y * x33; x45 -= l.z * x34; x45 -= l.w * x35; } { const v4f l = GDN_L4(45, 9); x45 -= l.x * x36; x45 -= l.y * x37; x45 -= l.z * x38; x45 -= l.w * x39; } { const v4f l = GDN_L4(45, 10); x45 -= l.x * x40; x45 -= l.y * x41; x45 -= l.z * x42; x45 -= l.w * x43; } { const v4f l = GDN_L4(45, 11); x45 -= l.x * x44; } __builtin_amdgcn_sched_barrier(0);
        float x46 = GDN_RHS(46); { const v4f l = GDN_L4(46, 0); x46 -= l.x * x0; x46 -= l.y * x1; x46 -= l.z * x2; x46 -= l.w * x3; } { const v4f l = GDN_L4(46, 1); x46 -= l.x * x4; x46 -= l.y * x5; x46 -= l.z * x6; x46 -= l.w * x7; } { const v4f l = GDN_L4(46, 2); x46 -= l.x * x8; x46 -= l.y * x9; x46 -= l.z * x10; x46 -= l.w * x11; } { const v4f l = GDN_L4(46, 3); x46 -= l.x * x12; x46 -= l.y * x13; x46 -= l.z * x14; x46 -= l.w * x15; } { const v4f l = GDN_L4(46, 4); x46 -= l.x * x16; x46 -= l.y * x17; x46 -= l.z * x18; x46 -= l.w * x19; } { const v4f l = GDN_L4(46, 5); x46 -= l.x * x20; x46 -= l.y * x21; x46 -= l.z * x22; x46 -= l.w * x23; } { const v4f l = GDN_L4(46, 6); x46 -= l.x * x24; x46 -= l.y * x25; x46 -= l.z * x26; x46 -= l.w * x27; } { const v4f l = GDN_L4(46, 7); x46 -= l.x * x28; x46 -= l.y * x29; x46 -= l.z * x30; x46 -= l.w * x31; } { const v4f l = GDN_L4(46, 8); x46 -= l.x * x32; x46 -= l.y * x33; x46 -= l.z * x34; x46 -= l.w * x35; } { const v4f l = GDN_L4(46, 9); x46 -= l.x * x36; x46 -= l.y * x37; x46 -= l.z * x38; x46 -= l.w * x39; } { const v4f l = GDN_L4(46, 10); x46 -= l.x * x40; x46 -= l.y * x41; x46 -= l.z * x42; x46 -= l.w * x43; } { const v4f l = GDN_L4(46, 11); x46 -= l.x * x44; x46 -= l.y * x45; } __builtin_amdgcn_sched_barrier(0);
        float x47 = GDN_RHS(47); { const v4f l = GDN_L4(47, 0); x47 -= l.x * x0; x47 -= l.y * x1; x47 -= l.z * x2; x47 -= l.w * x3; } { const v4f l = GDN_L4(47, 1); x47 -= l.x * x4; x47 -= l.y * x5; x47 -= l.z * x6; x47 -= l.w * x7; } { const v4f l = GDN_L4(47, 2); x47 -= l.x * x8; x47 -= l.y * x9; x47 -= l.z * x10; x47 -= l.w * x11; } { const v4f l = GDN_L4(47, 3); x47 -= l.x * x12; x47 -= l.y * x13; x47 -= l.z * x14; x47 -= l.w * x15; } { const v4f l = GDN_L4(47, 4); x47 -= l.x * x16; x47 -= l.y * x17; x47 -= l.z * x18; x47 -= l.w * x19; } { const v4f l = GDN_L4(47, 5); x47 -= l.x * x20; x47 -= l.y * x21; x47 -= l.z * x22; x47 -= l.w * x23; } { const v4f l = GDN_L4(47, 6); x47 -= l.x * x24; x47 -= l.y * x25; x47 -= l.z * x26; x47 -= l.w * x27; } { const v4f l = GDN_L4(47, 7); x47 -= l.x * x28; x47 -= l.y * x29; x47 -= l.z * x30; x47 -= l.w * x31; } { const v4f l = GDN_L4(47, 8); x47 -= l.x * x32; x47 -= l.y * x33; x47 -= l.z * x34; x47 -= l.w * x35; } { const v4f l = GDN_L4(47, 9); x47 -= l.x * x36; x47 -= l.y * x37; x47 -= l.z * x38; x47 -= l.w * x39; } { const v4f l = GDN_L4(47, 10); x47 -= l.x * x40; x47 -= l.y * x41; x47 -= l.z * x42; x47 -= l.w * x43; } { const v4f l = GDN_L4(47, 11); x47 -= l.x * x44; x47 -= l.y * x45; x47 -= l.z * x46; } __builtin_amdgcn_sched_barrier(0);
        float x48 = GDN_RHS(48); { const v4f l = GDN_L4(48, 0); x48 -= l.x * x0; x48 -= l.y * x1; x48 -= l.z * x2; x48 -= l.w * x3; } { const v4f l = GDN_L4(48, 1); x48 -= l.x * x4; x48 -= l.y * x5; x48 -= l.z * x6; x48 -= l.w * x7; } { const v4f l = GDN_L4(48, 2); x48 -= l.x * x8; x48 -= l.y * x9; x48 -= l.z * x10; x48 -= l.w * x11; } { const v4f l = GDN_L4(48, 3); x48 -= l.x * x12; x48 -= l.y * x13; x48 -= l.z * x14; x48 -= l.w * x15; } { const v4f l = GDN_L4(48, 4); x48 -= l.x * x16; x48 -= l.y * x17; x48 -= l.z * x18; x48 -= l.w * x19; } { const v4f l = GDN_L4(48, 5); x48 -= l.x * x20; x48 -= l.y * x21; x48 -= l.z * x22; x48 -= l.w * x23; } { const v4f l = GDN_L4(48, 6); x48 -= l.x * x24; x48 -= l.y * x25; x48 -= l.z * x26; x48 -= l.w * x27; } { const v4f l = GDN_L4(48, 7); x48 -= l.x * x28; x48 -= l.y * x29; x48 -= l.z * x30; x48 -= l.w * x31; } { const v4f l = GDN_L4(48, 8); x48 -= l.x * x32; x48 -= l.y * x33; x48 -= l.z * x34; x48 -= l.w * x35; } { const v4f l = GDN_L4(48, 9); x48 -= l.x * x36; x48 -= l.y * x37; x48 -= l.z * x38; x48 -= l.w * x39; } { const v4f l = GDN_L4(48, 10); x48 -= l.x * x40; x48 -= l.y * x41; x48 -= l.z * x42; x48 -= l.w * x43; } { const v4f l = GDN_L4(48, 11); x48 -= l.x * x44; x48 -= l.y * x45; x48 -= l.z * x46; x48 -= l.w * x47; } __builtin_amdgcn_sched_barrier(0);
        float x49 = GDN_RHS(49); { const v4f l = GDN_L4(49, 0); x49 -= l.x * x0; x49 -= l.y * x1; x49 -= l.z * x2; x49 -= l.w * x3; } { const v4f l = GDN_L4(49, 1); x49 -= l.x * x4; x49 -= l.y * x5; x49 -= l.z * x6; x49 -= l.w * x7; } { const v4f l = GDN_L4(49, 2); x49 -= l.x * x8; x49 -= l.y * x9; x49 -= l.z * x10; x49 -= l.w * x11; } { const v4f l = GDN_L4(49, 3); x49 -= l.x * x12; x49 -= l.y * x13; x49 -= l.z * x14; x49 -= l.w * x15; } { const v4f l = GDN_L4(49, 4); x49 -= l.x * x16; x49 -= l.y * x17; x49 -= l.z * x18; x49 -= l.w * x19; } { const v4f l = GDN_L4(49, 5); x49 -= l.x * x20; x49 -= l.y * x21; x49 -= l.z * x22; x49 -= l.w * x23; } { const v4f l = GDN_L4(49, 6); x49 -= l.x * x24; x49 -= l.y * x25; x49 -= l.z * x26; x49 -= l.w * x27; } { const v4f l = GDN_L4(49, 7); x49 -= l.x * x28; x49 -= l.y * x29; x49 -= l.z * x30; x49 -= l.w * x31; } { const v4f l = GDN_L4(49, 8); x49 -= l.x * x32; x49 -= l.y * x33; x49 -= l.z * x34; x49 -= l.w * x35; } { const v4f l = GDN_L4(49, 9); x49 -= l.x * x36; x49 -= l.y * x37; x49 -= l.z * x38; x49 -= l.w * x39; } { const v4f l = GDN_L4(49, 10); x49 -= l.x * x40; x49 -= l.y * x41; x49 -= l.z * x42; x49 -= l.w * x43; } { const v4f l = GDN_L4(49, 11); x49 -= l.x * x44; x49 -= l.y * x45; x49 -= l.z * x46; x49 -= l.w * x47; } { const v4f l = GDN_L4(49, 12); x49 -= l.x * x48; } __builtin_amdgcn_sched_barrier(0);
        float x50 = GDN_RHS(50); { const v4f l = GDN_L4(50, 0); x50 -= l.x * x0; x50 -= l.y * x1; x50 -= l.z * x2; x50 -= l.w * x3; } { const v4f l = GDN_L4(50, 1); x50 -= l.x * x4; x50 -= l.y * x5; x50 -= l.z * x6; x50 -= l.w * x7; } { const v4f l = GDN_L4(50, 2); x50 -= l.x * x8; x50 -= l.y * x9; x50 -= l.z * x10; x50 -= l.w * x11; } { const v4f l = GDN_L4(50, 3); x50 -= l.x * x12; x50 -= l.y * x13; x50 -= l.z * x14; x50 -= l.w * x15; } { const v4f l = GDN_L4(50, 4); x50 -= l.x * x16; x50 -= l.y * x17; x50 -= l.z * x18; x50 -= l.w * x19; } { const v4f l = GDN_L4(50, 5); x50 -= l.x * x20; x50 -= l.y * x21; x50 -= l.z * x22; x50 -= l.w * x23; } { const v4f l = GDN_L4(50, 6); x50 -= l.x * x24; x50 -= l.y * x25; x50 -= l.z * x26; x50 -= l.w * x27; } { const v4f l = GDN_L4(50, 7); x50 -= l.x * x28; x50 -= l.y * x29; x50 -= l.z * x30; x50 -= l.w * x31; } { const v4f l = GDN_L4(50, 8); x50 -= l.x * x32; x50 -= l.y * x33; x50 -= l.z * x34; x50 -= l.w * x35; } { const v4f l = GDN_L4(50, 9); x50 -= l.x * x36; x50 -= l.y * x37; x50 -= l.z * x38; x50 -= l.w * x39; } { const v4f l = GDN_L4(50, 10); x50 -= l.x * x40; x50 -= l.y * x41; x50 -= l.z * x42; x50 -= l.w * x43; } { const v4f l = GDN_L4(50, 11); x50 -= l.x * x44; x50 -= l.y * x45; x50 -= l.z * x46; x50 -= l.w * x47; } { const v4f l = GDN_L4(50, 12); x50 -= l.x * x48; x50 -= l.y * x49; } __builtin_amdgcn_sched_barrier(0);
        float x51 = GDN_RHS(51); { const v4f l = GDN_L4(51, 0); x51 -= l.x * x0; x51 -= l.y * x1; x51 -= l.z * x2; x51 -= l.w * x3; } { const v4f l = GDN_L4(51, 1); x51 -= l.x * x4; x51 -= l.y * x5; x51 -= l.z * x6; x51 -= l.w * x7; } { const v4f l = GDN_L4(51, 2); x51 -= l.x * x8; x51 -= l.y * x9; x51 -= l.z * x10; x51 -= l.w * x11; } { const v4f l = GDN_L4(51, 3); x51 -= l.x * x12; x51 -= l.y * x13; x51 -= l.z * x14; x51 -= l.w * x15; } { const v4f l = GDN_L4(51, 4); x51 -= l.x * x16; x51 -= l.y * x17; x51 -= l.z * x18; x51 -= l.w * x19; } { const v4f l = GDN_L4(51, 5); x51 -= l.x * x20; x51 -= l.y * x21; x51 -= l.z * x22; x51 -= l.w * x23; } { const v4f l = GDN_L4(51, 6); x51 -= l.x * x24; x51 -= l.y * x25; x51 -= l.z * x26; x51 -= l.w * x27; } { const v4f l = GDN_L4(51, 7); x51 -= l.x * x28; x51 -= l.y * x29; x51 -= l.z * x30; x51 -= l.w * x31; } { const v4f l = GDN_L4(51, 8); x51 -= l.x * x32; x51 -= l.y * x33; x51 -= l.z * x34; x51 -= l.w * x35; } { const v4f l = GDN_L4(51, 9); x51 -= l.x * x36; x51 -= l.y * x37; x51 -= l.z * x38; x51 -= l.w * x39; } { const v4f l = GDN_L4(51, 10); x51 -= l.x * x40; x51 -= l.y * x41; x51 -= l.z * x42; x51 -= l.w * x43; } { const v4f l = GDN_L4(51, 11); x51 -= l.x * x44; x51 -= l.y * x45; x51 -= l.z * x46; x51 -= l.w * x47; } { const v4f l = GDN_L4(51, 12); x51 -= l.x * x48; x51 -= l.y * x49; x51 -= l.z * x50; } __builtin_amdgcn_sched_barrier(0);
        float x52 = GDN_RHS(52); { const v4f l = GDN_L4(52, 0); x52 -= l.x * x0; x52 -= l.y * x1; x52 -= l.z * x2; x52 -= l.w * x3; } { const v4f l = GDN_L4(52, 1); x52 -= l.x * x4; x52 -= l.y * x5; x52 -= l.z * x6; x52 -= l.w * x7; } { const v4f l = GDN_L4(52, 2); x52 -= l.x * x8; x52 -= l.y * x9; x52 -= l.z * x10; x52 -= l.w * x11; } { const v4f l = GDN_L4(52, 3); x52 -= l.x * x12; x52 -= l.y * x13; x52 -= l.z * x14; x52 -= l.w * x15; } { const v4f l = GDN_L4(52, 4); x52 -= l.x * x16; x52 -= l.y * x17; x52 -= l.z * x18; x52 -= l.w * x19; } { const v4f l = GDN_L4(52, 5); x52 -= l.x * x20; x52 -= l.y * x21; x52 -= l.z * x22; x52 -= l.w * x23; } { const v4f l = GDN_L4(52, 6); x52 -= l.x * x24; x52 -= l.y * x25; x52 -= l.z * x26; x52 -= l.w * x27; } { const v4f l = GDN_L4(52, 7); x52 -= l.x * x28; x52 -= l.y * x29; x52 -= l.z * x30; x52 -= l.w * x31; } { const v4f l = GDN_L4(52, 8); x52 -= l.x * x32; x52 -= l.y * x33; x52 -= l.z * x34; x52 -= l.w * x35; } { const v4f l = GDN_L4(52, 9); x52 -= l.x * x36; x52 -= l.y * x37; x52 -= l.z * x38; x52 -= l.w * x39; } { const v4f l = GDN_L4(52, 10); x52 -= l.x * x40; x52 -= l.y * x41; x52 -= l.z * x42; x52 -= l.w * x43; } { const v4f l = GDN_L4(52, 11); x52 -= l.x * x44; x52 -= l.y * x45; x52 -= l.z * x46; x52 -= l.w * x47; } { const v4f l = GDN_L4(52, 12); x52 -= l.x * x48; x52 -= l.y * x49; x52 -= l.z * x50; x52 -= l.w * x51; } __builtin_amdgcn_sched_barrier(0);
        float x53 = GDN_RHS(53); { const v4f l = GDN_L4(53, 0); x53 -= l.x * x0; x53 -= l.y * x1; x53 -= l.z * x2; x53 -= l.w * x3; } { const v4f l = GDN_L4(53, 1); x53 -= l.x * x4; x53 -= l.y * x5; x53 -= l.z * x6; x53 -= l.w * x7; } { const v4f l = GDN_L4(53, 2); x53 -= l.x * x8; x53 -= l.y * x9; x53 -= l.z * x10; x53 -= l.w * x11; } { const v4f l = GDN_L4(53, 3); x53 -= l.x * x12; x53 -= l.y * x13; x53 -= l.z * x14; x53 -= l.w * x15; } { const v4f l = GDN_L4(53, 4); x53 -= l.x * x16; x53 -= l.y * x17; x53 -= l.z * x18; x53 -= l.w * x19; } { const v4f l = GDN_L4(53, 5); x53 -= l.x * x20; x53 -= l.y * x21; x53 -= l.z * x22; x53 -= l.w * x23; } { const v4f l = GDN_L4(53, 6); x53 -= l.x * x24; x53 -= l.y * x25; x53 -= l.z * x26; x53 -= l.w * x27; } { const v4f l = GDN_L4(53, 7); x53 -= l.x * x28; x53 -= l.y * x29; x53 -= l.z * x30; x53 -= l.w * x31; } { const v4f l = GDN_L4(53, 8); x53 -= l.x * x32; x53 -= l.y * x33; x53 -= l.z * x34; x53 -= l.w * x35; } { const v4f l = GDN_L4(53, 9); x53 -= l.x * x36; x53 -= l.y * x37; x53 -= l.z * x38; x53 -= l.w * x39; } { const v4f l = GDN_L4(53, 10); x53 -= l.x * x40; x53 -= l.y * x41; x53 -= l.z * x42; x53 -= l.w * x43; } { const v4f l = GDN_L4(53, 11); x53 -= l.x * x44; x53 -= l.y * x45; x53 -= l.z * x46; x53 -= l.w * x47; } { const v4f l = GDN_L4(53, 12); x53 -= l.x * x48; x53 -= l.y * x49; x53 -= l.z * x50; x53 -= l.w * x51; } { const v4f l = GDN_L4(53, 13); x53 -= l.x * x52; } __builtin_amdgcn_sched_barrier(0);
        float x54 = GDN_RHS(54); { const v4f l = GDN_L4(54, 0); x54 -= l.x * x0; x54 -= l.y * x1; x54 -= l.z * x2; x54 -= l.w * x3; } { const v4f l = GDN_L4(54, 1); x54 -= l.x * x4; x54 -= l.y * x5; x54 -= l.z * x6; x54 -= l.w * x7; } { const v4f l = GDN_L4(54, 2); x54 -= l.x * x8; x54 -= l.y * x9; x54 -= l.z * x10; x54 -= l.w * x11; } { const v4f l = GDN_L4(54, 3); x54 -= l.x * x12; x54 -= l.y * x13; x54 -= l.z * x14; x54 -= l.w * x15; } { const v4f l = GDN_L4(54, 4); x54 -= l.x * x16; x54 -= l.y * x17; x54 -= l.z * x18; x54 -= l.w * x19; } { const v4f l = GDN_L4(54, 5); x54 -= l.x * x20; x54 -= l.y * x21; x54 -= l.z * x22; x54 -= l.w * x23; } { const v4f l = GDN_L4(54, 6); x54 -= l.x * x24; x54 -= l.y * x25; x54 -= l.z * x26; x54 -= l.w * x27; } { const v4f l = GDN_L4(54, 7); x54 -= l.x * x28; x54 -= l.y * x29; x54 -= l.z * x30; x54 -= l.w * x31; } { const v4f l = GDN_L4(54, 8); x54 -= l.x * x32; x54 -= l.y * x33; x54 -= l.z * x34; x54 -= l.w * x35; } { const v4f l = GDN_L4(54, 9); x54 -= l.x * x36; x54 -= l.y * x37; x54 -= l.z * x38; x54 -= l.w * x39; } { const v4f l = GDN_L4(54, 10); x54 -= l.x * x40; x54 -= l.y * x41; x54 -= l.z * x42; x54 -= l.w * x43; } { const v4f l = GDN_L4(54, 11); x54 -= l.x * x44; x54 -= l.y * x45; x54 -= l.z * x46; x54 -= l.w * x47; } { const v4f l = GDN_L4(54, 12); x54 -= l.x * x48; x54 -= l.y * x49; x54 -= l.z * x50; x54 -= l.w * x51; } { const v4f l = GDN_L4(54, 13); x54 -= l.x * x52; x54 -= l.y * x53; } __builtin_amdgcn_sched_barrier(0);
        float x55 = GDN_RHS(55); { const v4f l = GDN_L4(55, 0); x55 -= l.x * x0; x55 -= l.y * x1; x55 -= l.z * x2; x55 -= l.w * x3; } { const v4f l = GDN_L4(55, 1); x55 -= l.x * x4; x55 -= l.y * x5; x55 -= l.z * x6; x55 -= l.w * x7; } { const v4f l = GDN_L4(55, 2); x55 -= l.x * x8; x55 -= l.y * x9; x55 -= l.z * x10; x55 -= l.w * x11; } { const v4f l = GDN_L4(55, 3); x55 -= l.x * x12; x55 -= l.y * x13; x55 -= l.z * x14; x55 -= l.w * x15; } { const v4f l = GDN_L4(55, 4); x55 -= l.x * x16; x55 -= l.y * x17; x55 -= l.z * x18; x55 -= l.w * x19; } { const v4f l = GDN_L4(55, 5); x55 -= l.x * x20; x55 -= l.y * x21; x55 -= l.z * x22; x55 -= l.w * x23; } { const v4f l = GDN_L4(55, 6); x55 -= l.x * x24; x55 -= l.y * x25; x55 -= l.z * x26; x55 -= l.w * x27; } { const v4f l = GDN_L4(55, 7); x55 -= l.x * x28; x55 -= l.y * x29; x55 -= l.z * x30; x55 -= l.w * x31; } { const v4f l = GDN_L4(55, 8); x55 -= l.x * x32; x55 -= l.y * x33; x55 -= l.z * x34; x55 -= l.w * x35; } { const v4f l = GDN_L4(55, 9); x55 -= l.x * x36; x55 -= l.y * x37; x55 -= l.z * x38; x55 -= l.w * x39; } { const v4f l = GDN_L4(55, 10); x55 -= l.x * x40; x55 -= l.y * x41; x55 -= l.z * x42; x55 -= l.w * x43; } { const v4f l = GDN_L4(55, 11); x55 -= l.x * x44; x55 -= l.y * x45; x55 -= l.z * x46; x55 -= l.w * x47; } { const v4f l = GDN_L4(55, 12); x55 -= l.x * x48; x55 -= l.y * x49; x55 -= l.z * x50; x55 -= l.w * x51; } { const v4f l = GDN_L4(55, 13); x55 -= l.x * x52; x55 -= l.y * x53; x55 -= l.z * x54; } __builtin_amdgcn_sched_barrier(0);
        float x56 = GDN_RHS(56); { const v4f l = GDN_L4(56, 0); x56 -= l.x * x0; x56 -= l.y * x1; x56 -= l.z * x2; x56 -= l.w * x3; } { const v4f l = GDN_L4(56, 1); x56 -= l.x * x4; x56 -= l.y * x5; x56 -= l.z * x6; x56 -= l.w * x7; } { const v4f l = GDN_L4(56, 2); x56 -= l.x * x8; x56 -= l.y * x9; x56 -= l.z * x10; x56 -= l.w * x11; } { const v4f l = GDN_L4(56, 3); x56 -= l.x * x12; x56 -= l.y * x13; x56 -= l.z * x14; x56 -= l.w * x15; } { const v4f l = GDN_L4(56, 4); x56 -= l.x * x16; x56 -= l.y * x17; x56 -= l.z * x18; x56 -= l.w * x19; } { const v4f l = GDN_L4(56, 5); x56 -= l.x * x20; x56 -= l.y * x21; x56 -= l.z * x22; x56 -= l.w * x23; } { const v4f l = GDN_L4(56, 6); x56 -= l.x * x24; x56 -= l.y * x25; x56 -= l.z * x26; x56 -= l.w * x27; } { const v4f l = GDN_L4(56, 7); x56 -= l.x * x28; x56 -= l.y * x29; x56 -= l.z * x30; x56 -= l.w * x31; } { const v4f l = GDN_L4(56, 8); x56 -= l.x * x32; x56 -= l.y * x33; x56 -= l.z * x34; x56 -= l.w * x35; } { const v4f l = GDN_L4(56, 9); x56 -= l.x * x36; x56 -= l.y * x37; x56 -= l.z * x38; x56 -= l.w * x39; } { const v4f l = GDN_L4(56, 10); x56 -= l.x * x40; x56 -= l.y * x41; x56 -= l.z * x42; x56 -= l.w * x43; } { const v4f l = GDN_L4(56, 11); x56 -= l.x * x44; x56 -= l.y * x45; x56 -= l.z * x46; x56 -= l.w * x47; } { const v4f l = GDN_L4(56, 12); x56 -= l.x * x48; x56 -= l.y * x49; x56 -= l.z * x50; x56 -= l.w * x51; } { const v4f l = GDN_L4(56, 13); x56 -= l.x * x52; x56 -= l.y * x53; x56 -= l.z * x54; x56 -= l.w * x55; } __builtin_amdgcn_sched_barrier(0);
        float x57 = GDN_RHS(57); { const v4f l = GDN_L4(57, 0); x57 -= l.x * x0; x57 -= l.y * x1; x57 -= l.z * x2; x57 -= l.w * x3; } { const v4f l = GDN_L4(57, 1); x57 -= l.x * x4; x57 -= l.y * x5; x57 -= l.z * x6; x57 -= l.w * x7; } { const v4f l = GDN_L4(57, 2); x57 -= l.x * x8; x57 -= l.y * x9; x57 -= l.z * x10; x57 -= l.w * x11; } { const v4f l = GDN_L4(57, 3); x57 -= l.x * x12; x57 -= l.y * x13; x57 -= l.z * x14; x57 -= l.w * x15; } { const v4f l = GDN_L4(57, 4); x57 -= l.x * x16; x57 -= l.y * x17; x57 -= l.z * x18; x57 -= l.w * x19; } { const v4f l = GDN_L4(57, 5); x57 -= l.x * x20; x57 -= l.y * x21; x57 -= l.z * x22; x57 -= l.w * x23; } { const v4f l = GDN_L4(57, 6); x57 -= l.x * x24; x57 -= l.y * x25; x57 -= l.z * x26; x57 -= l.w * x27; } { const v4f l = GDN_L4(57, 7); x57 -= l.x * x28; x57 -= l.y * x29; x57 -= l.z * x30; x57 -= l.w * x31; } { const v4f l = GDN_L4(57, 8); x57 -= l.x * x32; x57 -= l.y * x33; x57 -= l.z * x34; x57 -= l.w * x35; } { const v4f l = GDN_L4(57, 9); x57 -= l.x * x36; x57 -= l.y * x37; x57 -= l.z * x38; x57 -= l.w * x39; } { const v4f l = GDN_L4(57, 10); x57 -= l.x * x40; x57 -= l.y * x41; x57 -= l.z * x42; x57 -= l.w * x43; } { const v4f l = GDN_L4(57, 11); x57 -= l.x * x44; x57 -= l.y * x45; x57 -= l.z * x46; x57 -= l.w * x47; } { const v4f l = GDN_L4(57, 12); x57 -= l.x * x48; x57 -= l.y * x49; x57 -= l.z * x50; x57 -= l.w * x51; } { const v4f l = GDN_L4(57, 13); x57 -= l.x * x52; x57 -= l.y * x53; x57 -= l.z * x54; x57 -= l.w * x55; } { const v4f l = GDN_L4(57, 14); x57 -= l.x * x56; } __builtin_amdgcn_sched_barrier(0);
        float x58 = GDN_RHS(58); { const v4f l = GDN_L4(58, 0); x58 -= l.x * x0; x58 -= l.y * x1; x58 -= l.z * x2; x58 -= l.w * x3; } { const v4f l = GDN_L4(58, 1); x58 -= l.x * x4; x58 -= l.y * x5; x58 -= l.z * x6; x58 -= l.w * x7; } { const v4f l = GDN_L4(58, 2); x58 -= l.x * x8; x58 -= l.y * x9; x58 -= l.z * x10; x58 -= l.w * x11; } { const v4f l = GDN_L4(58, 3); x58 -= l.x * x12; x58 -= l.y * x13; x58 -= l.z * x14; x58 -= l.w * x15; } { const v4f l = GDN_L4(58, 4); x58 -= l.x * x16; x58 -= l.y * x17; x58 -= l.z * x18; x58 -= l.w * x19; } { const v4f l = GDN_L4(58, 5); x58 -= l.x * x20; x58 -= l.y * x21; x58 -= l.z * x22; x58 -= l.w * x23; } { const v4f l = GDN_L4(58, 6); x58 -= l.x * x24; x58 -= l.y * x25; x58 -= l.z * x26; x58 -= l.w * x27; } { const v4f l = GDN_L4(58, 7); x58 -= l.x * x28; x58 -= l.y * x29; x58 -= l.z * x30; x58 -= l.w * x31; } { const v4f l = GDN_L4(58, 8); x58 -= l.x * x32; x58 -= l.y * x33; x58 -= l.z * x34; x58 -= l.w * x35; } { const v4f l = GDN_L4(58, 9); x58 -= l.x * x36; x58 -= l.y * x37; x58 -= l.z * x38; x58 -= l.w * x39; } { const v4f l = GDN_L4(58, 10); x58 -= l.x * x40; x58 -= l.y * x41; x58 -= l.z * x42; x58 -= l.w * x43; } { const v4f l = GDN_L4(58, 11); x58 -= l.x * x44; x58 -= l.y * x45; x58 -= l.z * x46; x58 -= l.w * x47; } { const v4f l = GDN_L4(58, 12); x58 -= l.x * x48; x58 -= l.y * x49; x58 -= l.z * x50; x58 -= l.w * x51; } { const v4f l = GDN_L4(58, 13); x58 -= l.x * x52; x58 -= l.y * x53; x58 -= l.z * x54; x58 -= l.w * x55; } { const v4f l = GDN_L4(58, 14); x58 -= l.x * x56; x58 -= l.y * x57; } __builtin_amdgcn_sched_barrier(0);
        float x59 = GDN_RHS(59); { const v4f l = GDN_L4(59, 0); x59 -= l.x * x0; x59 -= l.y * x1; x59 -= l.z * x2; x59 -= l.w * x3; } { const v4f l = GDN_L4(59, 1); x59 -= l.x * x4; x59 -= l.y * x5; x59 -= l.z * x6; x59 -= l.w * x7; } { const v4f l = GDN_L4(59, 2); x59 -= l.x * x8; x59 -= l.y * x9; x59 -= l.z * x10; x59 -= l.w * x11; } { const v4f l = GDN_L4(59, 3); x59 -= l.x * x12; x59 -= l.y * x13; x59 -= l.z * x14; x59 -= l.w * x15; } { const v4f l = GDN_L4(59, 4); x59 -= l.x * x16; x59 -= l.y * x17; x59 -= l.z * x18; x59 -= l.w * x19; } { const v4f l = GDN_L4(59, 5); x59 -= l.x * x20; x59 -= l.y * x21; x59 -= l.z * x22; x59 -= l.w * x23; } { const v4f l = GDN_L4(59, 6); x59 -= l.x * x24; x59 -= l.y * x25; x59 -= l.z * x26; x59 -= l.w * x27; } { const v4f l = GDN_L4(59, 7); x59 -= l.x * x28; x59 -= l.y * x29; x59 -= l.z * x30; x59 -= l.w * x31; } { const v4f l = GDN_L4(59, 8); x59 -= l.x * x32; x59 -= l.y * x33; x59 -= l.z * x34; x59 -= l.w * x35; } { const v4f l = GDN_L4(59, 9); x59 -= l.x * x36; x59 -= l.y * x37; x59 -= l.z * x38; x59 -= l.w * x39; } { const v4f l = GDN_L4(59, 10); x59 -= l.x * x40; x59 -= l.y * x41; x59 -= l.z * x42; x59 -= l.w * x43; } { const v4f l = GDN_L4(59, 11); x59 -= l.x * x44; x59 -= l.y * x45; x59 -= l.z * x46; x59 -= l.w * x47; } { const v4f l = GDN_L4(59, 12); x59 -= l.x * x48; x59 -= l.y * x49; x59 -= l.z * x50; x59 -= l.w * x51; } { const v4f l = GDN_L4(59, 13); x59 -= l.x * x52; x59 -= l.y * x53; x59 -= l.z * x54; x59 -= l.w * x55; } { const v4f l = GDN_L4(59, 14); x59 -= l.x * x56; x59 -= l.y * x57; x59 -= l.z * x58; } __builtin_amdgcn_sched_barrier(0);
        float x60 = GDN_RHS(60); { const v4f l = GDN_L4(60, 0); x60 -= l.x * x0; x60 -= l.y * x1; x60 -= l.z * x2; x60 -= l.w * x3; } { const v4f l = GDN_L4(60, 1); x60 -= l.x * x4; x60 -= l.y * x5; x60 -= l.z * x6; x60 -= l.w * x7; } { const v4f l = GDN_L4(60, 2); x60 -= l.x * x8; x60 -= l.y * x9; x60 -= l.z * x10; x60 -= l.w * x11; } { const v4f l = GDN_L4(60, 3); x60 -= l.x * x12; x60 -= l.y * x13; x60 -= l.z * x14; x60 -= l.w * x15; } { const v4f l = GDN_L4(60, 4); x60 -= l.x * x16; x60 -= l.y * x17; x60 -= l.z * x18; x60 -= l.w * x19; } { const v4f l = GDN_L4(60, 5); x60 -= l.x * x20; x60 -= l.y * x21; x60 -= l.z * x22; x60 -= l.w * x23; } { const v4f l = GDN_L4(60, 6); x60 -= l.x * x24; x60 -= l.y * x25; x60 -= l.z * x26; x60 -= l.w * x27; } { const v4f l = GDN_L4(60, 7); x60 -= l.x * x28; x60 -= l.y * x29; x60 -= l.z * x30; x60 -= l.w * x31; } { const v4f l = GDN_L4(60, 8); x60 -= l.x * x32; x60 -= l.y * x33; x60 -= l.z * x34; x60 -= l.w * x35; } { const v4f l = GDN_L4(60, 9); x60 -= l.x * x36; x60 -= l.y * x37; x60 -= l.z * x38; x60 -= l.w * x39; } { const v4f l = GDN_L4(60, 10); x60 -= l.x * x40; x60 -= l.y * x41; x60 -= l.z * x42; x60 -= l.w * x43; } { const v4f l = GDN_L4(60, 11); x60 -= l.x * x44; x60 -= l.y * x45; x60 -= l.z * x46; x60 -= l.w * x47; } { const v4f l = GDN_L4(60, 12); x60 -= l.x * x48; x60 -= l.y * x49; x60 -= l.z * x50; x60 -= l.w * x51; } { const v4f l = GDN_L4(60, 13); x60 -= l.x * x52; x60 -= l.y * x53; x60 -= l.z * x54; x60 -= l.w * x55; } { const v4f l = GDN_L4(60, 14); x60 -= l.x * x56; x60 -= l.y * x57; x60 -= l.z * x58; x60 -= l.w * x59; } __builtin_amdgcn_sched_barrier(0);
        float x61 = GDN_RHS(61); { const v4f l = GDN_L4(61, 0); x61 -= l.x * x0; x61 -= l.y * x1; x61 -= l.z * x2; x61 -= l.w * x3; } { const v4f l = GDN_L4(61, 1); x61 -= l.x * x4; x61 -= l.y * x5; x61 -= l.z * x6; x61 -= l.w * x7; } { const v4f l = GDN_L4(61, 2); x61 -= l.x * x8; x61 -= l.y * x9; x61 -= l.z * x10; x61 -= l.w * x11; } { const v4f l = GDN_L4(61, 3); x61 -= l.x * x12; x61 -= l.y * x13; x61 -= l.z * x14; x61 -= l.w * x15; } { const v4f l = GDN_L4(61, 4); x61 -= l.x * x16; x61 -= l.y * x17; x61 -= l.z * x18; x61 -= l.w * x19; } { const v4f l = GDN_L4(61, 5); x61 -= l.x * x20; x61 -= l.y * x21; x61 -= l.z * x22; x61 -= l.w * x23; } { const v4f l = GDN_L4(61, 6); x61 -= l.x * x24; x61 -= l.y * x25; x61 -= l.z * x26; x61 -= l.w * x27; } { const v4f l = GDN_L4(61, 7); x61 -= l.x * x28; x61 -= l.y * x29; x61 -= l.z * x30; x61 -= l.w * x31; } { const v4f l = GDN_L4(61, 8); x61 -= l.x * x32; x61 -= l.y * x33; x61 -= l.z * x34; x61 -= l.w * x35; } { const v4f l = GDN_L4(61, 9); x61 -= l.x * x36; x61 -= l.y * x37; x61 -= l.z * x38; x61 -= l.w * x39; } { const v4f l = GDN_L4(61, 10); x61 -= l.x * x40; x61 -= l.y * x41; x61 -= l.z * x42; x61 -= l.w * x43; } { const v4f l = GDN_L4(61, 11); x61 -= l.x * x44; x61 -= l.y * x45; x61 -= l.z * x46; x61 -= l.w * x47; } { const v4f l = GDN_L4(61, 12); x61 -= l.x * x48; x61 -= l.y * x49; x61 -= l.z * x50; x61 -= l.w * x51; } { const v4f l = GDN_L4(61, 13); x61 -= l.x * x52; x61 -= l.y * x53; x61 -= l.z * x54; x61 -= l.w * x55; } { const v4f l = GDN_L4(61, 14); x61 -= l.x * x56; x61 -= l.y * x57; x61 -= l.z * x58; x61 -= l.w * x59; } { const v4f l = GDN_L4(61, 15); x61 -= l.x * x60; } __builtin_amdgcn_sched_barrier(0);
        float x62 = GDN_RHS(62); { const v4f l = GDN_L4(62, 0); x62 -= l.x * x0; x62 -= l.y * x1; x62 -= l.z * x2; x62 -= l.w * x3; } { const v4f l = GDN_L4(62, 1); x62 -= l.x * x4; x62 -= l.y * x5; x62 -= l.z * x6; x62 -= l.w * x7; } { const v4f l = GDN_L4(62, 2); x62 -= l.x * x8; x62 -= l.y * x9; x62 -= l.z * x10; x62 -= l.w * x11; } { const v4f l = GDN_L4(62, 3); x62 -= l.x * x12; x62 -= l.y * x13; x62 -= l.z * x14; x62 -= l.w * x15; } { const v4f l = GDN_L4(62, 4); x62 -= l.x * x16; x62 -= l.y * x17; x62 -= l.z * x18; x62 -= l.w * x19; } { const v4f l = GDN_L4(62, 5); x62 -= l.x * x20; x62 -= l.y * x21; x62 -= l.z * x22; x62 -= l.w * x23; } { const v4f l = GDN_L4(62, 6); x62 -= l.x * x24; x62 -= l.y * x25; x62 -= l.z * x26; x62 -= l.w * x27; } { const v4f l = GDN_L4(62, 7); x62 -= l.x * x28; x62 -= l.y * x29; x62 -= l.z * x30; x62 -= l.w * x31; } { const v4f l = GDN_L4(62, 8); x62 -= l.x * x32; x62 -= l.y * x33; x62 -= l.z * x34; x62 -= l.w * x35; } { const v4f l = GDN_L4(62, 9); x62 -= l.x * x36; x62 -= l.y * x37; x62 -= l.z * x38; x62 -= l.w * x39; } { const v4f l = GDN_L4(62, 10); x62 -= l.x * x40; x62 -= l.y * x41; x62 -= l.z * x42; x62 -= l.w * x43; } { const v4f l = GDN_L4(62, 11); x62 -= l.x * x44; x62 -= l.y * x45; x62 -= l.z * x46; x62 -= l.w * x47; } { const v4f l = GDN_L4(62, 12); x62 -= l.x * x48; x62 -= l.y * x49; x62 -= l.z * x50; x62 -= l.w * x51; } { const v4f l = GDN_L4(62, 13); x62 -= l.x * x52; x62 -= l.y * x53; x62 -= l.z * x54; x62 -= l.w * x55; } { const v4f l = GDN_L4(62, 14); x62 -= l.x * x56; x62 -= l.y * x57; x62 -= l.z * x58; x62 -= l.w * x59; } { const v4f l = GDN_L4(62, 15); x62 -= l.x * x60; x62 -= l.y * x61; } __builtin_amdgcn_sched_barrier(0);
        float x63 = GDN_RHS(63); { const v4f l = GDN_L4(63, 0); x63 -= l.x * x0; x63 -= l.y * x1; x63 -= l.z * x2; x63 -= l.w * x3; } { const v4f l = GDN_L4(63, 1); x63 -= l.x * x4; x63 -= l.y * x5; x63 -= l.z * x6; x63 -= l.w * x7; } { const v4f l = GDN_L4(63, 2); x63 -= l.x * x8; x63 -= l.y * x9; x63 -= l.z * x10; x63 -= l.w * x11; } { const v4f l = GDN_L4(63, 3); x63 -= l.x * x12; x63 -= l.y * x13; x63 -= l.z * x14; x63 -= l.w * x15; } { const v4f l = GDN_L4(63, 4); x63 -= l.x * x16; x63 -= l.y * x17; x63 -= l.z * x18; x63 -= l.w * x19; } { const v4f l = GDN_L4(63, 5); x63 -= l.x * x20; x63 -= l.y * x21; x63 -= l.z * x22; x63 -= l.w * x23; } { const v4f l = GDN_L4(63, 6); x63 -= l.x * x24; x63 -= l.y * x25; x63 -= l.z * x26; x63 -= l.w * x27; } { const v4f l = GDN_L4(63, 7); x63 -= l.x * x28; x63 -= l.y * x29; x63 -= l.z * x30; x63 -= l.w * x31; } { const v4f l = GDN_L4(63, 8); x63 -= l.x * x32; x63 -= l.y * x33; x63 -= l.z * x34; x63 -= l.w * x35; } { const v4f l = GDN_L4(63, 9); x63 -= l.x * x36; x63 -= l.y * x37; x63 -= l.z * x38; x63 -= l.w * x39; } { const v4f l = GDN_L4(63, 10); x63 -= l.x * x40; x63 -= l.y * x41; x63 -= l.z * x42; x63 -= l.w * x43; } { const v4f l = GDN_L4(63, 11); x63 -= l.x * x44; x63 -= l.y * x45; x63 -= l.z * x46; x63 -= l.w * x47; } { const v4f l = GDN_L4(63, 12); x63 -= l.x * x48; x63 -= l.y * x49; x63 -= l.z * x50; x63 -= l.w * x51; } { const v4f l = GDN_L4(63, 13); x63 -= l.x * x52; x63 -= l.y * x53; x63 -= l.z * x54; x63 -= l.w * x55; } { const v4f l = GDN_L4(63, 14); x63 -= l.x * x56; x63 -= l.y * x57; x63 -= l.z * x58; x63 -= l.w * x59; } { const v4f l = GDN_L4(63, 15); x63 -= l.x * x60; x63 -= l.y * x61; x63 -= l.z * x62; } __builtin_amdgcn_sched_barrier(0);
        if (c < 128) { GU[0 * 128 + c] = x0; GU[1 * 128 + c] = x1; GU[2 * 128 + c] = x2; GU[3 * 128 + c] = x3; GU[4 * 128 + c] = x4; GU[5 * 128 + c] = x5; GU[6 * 128 + c] = x6; GU[7 * 128 + c] = x7; GU[8 * 128 + c] = x8; GU[9 * 128 + c] = x9; GU[10 * 128 + c] = x10; GU[11 * 128 + c] = x11; GU[12 * 128 + c] = x12; GU[13 * 128 + c] = x13; GU[14 * 128 + c] = x14; GU[15 * 128 + c] = x15; GU[16 * 128 + c] = x16; GU[17 * 128 + c] = x17; GU[18 * 128 + c] = x18; GU[19 * 128 + c] = x19; GU[20 * 128 + c] = x20; GU[21 * 128 + c] = x21; GU[22 * 128 + c] = x22; GU[23 * 128 + c] = x23; GU[24 * 128 + c] = x24; GU[25 * 128 + c] = x25; GU[26 * 128 + c] = x26; GU[27 * 128 + c] = x27; GU[28 * 128 + c] = x28; GU[29 * 128 + c] = x29; GU[30 * 128 + c] = x30; GU[31 * 128 + c] = x31; GU[32 * 128 + c] = x32; GU[33 * 128 + c] = x33; GU[34 * 128 + c] = x34; GU[35 * 128 + c] = x35; GU[36 * 128 + c] = x36; GU[37 * 128 + c] = x37; GU[38 * 128 + c] = x38; GU[39 * 128 + c] = x39; GU[40 * 128 + c] = x40; GU[41 * 128 + c] = x41; GU[42 * 128 + c] = x42; GU[43 * 128 + c] = x43; GU[44 * 128 + c] = x44; GU[45 * 128 + c] = x45; GU[46 * 128 + c] = x46; GU[47 * 128 + c] = x47; GU[48 * 128 + c] = x48; GU[49 * 128 + c] = x49; GU[50 * 128 + c] = x50; GU[51 * 128 + c] = x51; GU[52 * 128 + c] = x52; GU[53 * 128 + c] = x53; GU[54 * 128 + c] = x54; GU[55 * 128 + c] = x55; GU[56 * 128 + c] = x56; GU[57 * 128 + c] = x57; GU[58 * 128 + c] = x58; GU[59 * 128 + c] = x59; GU[60 * 128 + c] = x60; GU[61 * 128 + c] = x61; GU[62 * 128 + c] = x62; GU[63 * 128 + c] = x63; }
        else { GNW[0 * 128 + (c - 128)] = (bf16)f2bf(-x0); GNW[1 * 128 + (c - 128)] = (bf16)f2bf(-x1); GNW[2 * 128 + (c - 128)] = (bf16)f2bf(-x2); GNW[3 * 128 + (c - 128)] = (bf16)f2bf(-x3); GNW[4 * 128 + (c - 128)] = (bf16)f2bf(-x4); GNW[5 * 128 + (c - 128)] = (bf16)f2bf(-x5); GNW[6 * 128 + (c - 128)] = (bf16)f2bf(-x6); GNW[7 * 128 + (c - 128)] = (bf16)f2bf(-x7); GNW[8 * 128 + (c - 128)] = (bf16)f2bf(-x8); GNW[9 * 128 + (c - 128)] = (bf16)f2bf(-x9); GNW[10 * 128 + (c - 128)] = (bf16)f2bf(-x10); GNW[11 * 128 + (c - 128)] = (bf16)f2bf(-x11); GNW[12 * 128 + (c - 128)] = (bf16)f2bf(-x12); GNW[13 * 128 + (c - 128)] = (bf16)f2bf(-x13); GNW[14 * 128 + (c - 128)] = (bf16)f2bf(-x14); GNW[15 * 128 + (c - 128)] = (bf16)f2bf(-x15); GNW[16 * 128 + (c - 128)] = (bf16)f2bf(-x16); GNW[17 * 128 + (c - 128)] = (bf16)f2bf(-x17); GNW[18 * 128 + (c - 128)] = (bf16)f2bf(-x18); GNW[19 * 128 + (c - 128)] = (bf16)f2bf(-x19); GNW[20 * 128 + (c - 128)] = (bf16)f2bf(-x20); GNW[21 * 128 + (c - 128)] = (bf16)f2bf(-x21); GNW[22 * 128 + (c - 128)] = (bf16)f2bf(-x22); GNW[23 * 128 + (c - 128)] = (bf16)f2bf(-x23); GNW[24 * 128 + (c - 128)] = (bf16)f2bf(-x24); GNW[25 * 128 + (c - 128)] = (bf16)f2bf(-x25); GNW[26 * 128 + (c - 128)] = (bf16)f2bf(-x26); GNW[27 * 128 + (c - 128)] = (bf16)f2bf(-x27); GNW[28 * 128 + (c - 128)] = (bf16)f2bf(-x28); GNW[29 * 128 + (c - 128)] = (bf16)f2bf(-x29); GNW[30 * 128 + (c - 128)] = (bf16)f2bf(-x30); GNW[31 * 128 + (c - 128)] = (bf16)f2bf(-x31); GNW[32 * 128 + (c - 128)] = (bf16)f2bf(-x32); GNW[33 * 128 + (c - 128)] = (bf16)f2bf(-x33); GNW[34 * 128 + (c - 128)] = (bf16)f2bf(-x34); GNW[35 * 128 + (c - 128)] = (bf16)f2bf(-x35); GNW[36 * 128 + (c - 128)] = (bf16)f2bf(-x36); GNW[37 * 128 + (c - 128)] = (bf16)f2bf(-x37); GNW[38 * 128 + (c - 128)] = (bf16)f2bf(-x38); GNW[39 * 128 + (c - 128)] = (bf16)f2bf(-x39); GNW[40 * 128 + (c - 128)] = (bf16)f2bf(-x40); GNW[41 * 128 + (c - 128)] = (bf16)f2bf(-x41); GNW[42 * 128 + (c - 128)] = (bf16)f2bf(-x42); GNW[43 * 128 + (c - 128)] = (bf16)f2bf(-x43); GNW[44 * 128 + (c - 128)] = (bf16)f2bf(-x44); GNW[45 * 128 + (c - 128)] = (bf16)f2bf(-x45); GNW[46 * 128 + (c - 128)] = (bf16)f2bf(-x46); GNW[47 * 128 + (c - 128)] = (bf16)f2bf(-x47); GNW[48 * 128 + (c - 128)] = (bf16)f2bf(-x48); GNW[49 * 128 + (c - 128)] = (bf16)f2bf(-x49); GNW[50 * 128 + (c - 128)] = (bf16)f2bf(-x50); GNW[51 * 128 + (c - 128)] = (bf16)f2bf(-x51); GNW[52 * 128 + (c - 128)] = (bf16)f2bf(-x52); GNW[53 * 128 + (c - 128)] = (bf16)f2bf(-x53); GNW[54 * 128 + (c - 128)] = (bf16)f2bf(-x54); GNW[55 * 128 + (c - 128)] = (bf16)f2bf(-x55); GNW[56 * 128 + (c - 128)] = (bf16)f2bf(-x56); GNW[57 * 128 + (c - 128)] = (bf16)f2bf(-x57); GNW[58 * 128 + (c - 128)] = (bf16)f2bf(-x58); GNW[59 * 128 + (c - 128)] = (bf16)f2bf(-x59); GNW[60 * 128 + (c - 128)] = (bf16)f2bf(-x60); GNW[61 * 128 + (c - 128)] = (bf16)f2bf(-x61); GNW[62 * 128 + (c - 128)] = (bf16)f2bf(-x62); GNW[63 * 128 + (c - 128)] = (bf16)f2bf(-x63); }
#undef GDN_RHS
#undef GDN_L4
    } else {
        const int t2 = tid - 256; const float gl = gcs[63];
        { const int i = t2 >> 2, d0 = (t2 & 3) * 32; const float e = __expf(gcs[i]);
#pragma unroll
          for (int x8 = 0; x8 < 4; ++x8) { const v4f a = *(const LAS v4f*)(qs + i * QP + d0 + 8 * x8), b = *(const LAS v4f*)(qs + i * QP + d0 + 8 * x8 + 4);
              v4u w; w.x = pk2(a.x * e, a.y * e); w.y = pk2(a.z * e, a.w * e); w.z = pk2(b.x * e, b.y * e); w.w = pk2(b.z * e, b.w * e); *(v4u*)(GQG + i * 128 + d0 + 8 * x8) = w; } }
        { const int d = t2 >> 1, j0 = (t2 & 1) * 32;
#pragma unroll
          for (int x8 = 0; x8 < 4; ++x8) { float o[8];
#pragma unroll
              for (int x = 0; x < 8; ++x) { const int j = j0 + 8 * x8 + x; o[x] = ks[j * QP + d] * __expf(gl - gcs[j]); }
              v4u w; w.x = pk2(o[0], o[1]); w.y = pk2(o[2], o[3]); w.z = pk2(o[4], o[5]); w.w = pk2(o[6], o[7]); *(v4u*)(GKT + d * 64 + j0 + 8 * x8) = w; } }
        if (t2 == 0) GDL[item] = __expf(gl);
    }
    __syncthreads();
}
struct GdnFrags { bf16x8_t nw[4], qg[4], at[2], kt[2][2]; float u[4]; float dl; };
__device__ __forceinline__ void gdn_load(GdnFrags& F, const Params& p, int item, int off128, int off64, int offk, int offu) {
    const bf16* GNW = (const bf16*)(p.ws + WS_GNW) + (size_t)item * 8192; const bf16* GQG = (const bf16*)(p.ws + WS_GQG) + (size_t)item * 8192;
    const bf16* GAT = (const bf16*)(p.ws + WS_GAT) + (size_t)item * 4096; const bf16* GKT = (const bf16*)(p.ws + WS_GKT) + (size_t)item * 8192; const float* GU = (const float*)(p.ws + WS_GU) + (size_t)item * 8192;
#pragma unroll
    for (int ks = 0; ks < 4; ++ks) { F.nw[ks] = *(const bf16x8_t*)(GNW + off128 + 32 * ks); F.qg[ks] = *(const bf16x8_t*)(GQG + off128 + 32 * ks); }
#pragma unroll
    for (int ks = 0; ks < 2; ++ks) { F.at[ks] = *(const bf16x8_t*)(GAT + off64 + 32 * ks); F.kt[0][ks] = *(const bf16x8_t*)(GKT + offk + 32 * ks); F.kt[1][ks] = *(const bf16x8_t*)(GKT + offk + 1024 + 32 * ks); }
#pragma unroll
    for (int r = 0; r < 4; ++r) F.u[r] = GU[offu + r * 128];
    F.dl = ((const float*)(p.ws + WS_GDL))[item];
}
constexpr int STP = 136, VNP = 72;
__device__ __forceinline__ void gdn_seq(const Params& p, LAS unsigned char* lds, int wgi, int wave, int lane) {
    const int u = wgi * 2 + (wave >> 2), wi = wave & 3, h = u >> 3, sl = u & 7, g = lane >> 4, c = lane & 15;
    LAS unsigned short* ST = (LAS unsigned short*)(lds + (wave >> 2) * 12288);
    LAS unsigned short* VNT = ST + 2 * 16 * STP;
    float* GO = (float*)(p.ws + WS_GO);
    const int off128 = (16 * wi + c) * 128 + 8 * g, off64 = (16 * wi + c) * 64 + 8 * g, offk = (32 * wi + c) * 64 + 8 * g, offu = (16 * wi + 4 * g) * 128 + 16 * sl + c;
#pragma unroll
    for (int mt = 0; mt < 2; ++mt) *(LAS v2u*)(ST + c * STP + 16 * (2 * wi + mt) + 4 * g) = (v2u){0u, 0u};
    pg8::f32x4 Sacc[2] = {{0.f, 0.f, 0.f, 0.f}, {0.f, 0.f, 0.f, 0.f}};
    __syncthreads();
    GdnFrags F0, F1;
    gdn_load(F0, p, h, off128, off64, offk, offu);
#define GDN_STEP(F, n_) do { const int cur = (n_) & 1; bf16x8_t sf[4]; \
        _Pragma("unroll") for (int ks = 0; ks < 4; ++ks) sf[ks] = *(const LAS bf16x8_t*)(ST + cur * 16 * STP + c * STP + 32 * ks + 8 * g); \
        pg8::f32x4 vn = {F.u[0], F.u[1], F.u[2], F.u[3]}; \
        _Pragma("unroll") for (int ks = 0; ks < 4; ++ks) vn = __builtin_amdgcn_mfma_f32_16x16x32_bf16(F.nw[ks], sf[ks], vn, 0, 0, 0); \
        { v2u w; w.x = pk2(vn[0], vn[1]); w.y = pk2(vn[2], vn[3]); *(LAS v2u*)(VNT + c * VNP + 16 * wi + 4 * g) = w; } \
        LDS_BAR(); \
        const bf16x8_t v0 = *(const LAS bf16x8_t*)(VNT + c * VNP + 8 * g), v1 = *(const LAS bf16x8_t*)(VNT + c * VNP + 32 + 8 * g); \
        pg8::f32x4 o = {0.f, 0.f, 0.f, 0.f}; \
        _Pragma("unroll") for (int ks = 0; ks < 4; ++ks) o = __builtin_amdgcn_mfma_f32_16x16x32_bf16(F.qg[ks], sf[ks], o, 0, 0, 0); \
        o = __builtin_amdgcn_mfma_f32_16x16x32_bf16(F.at[0], v0, o, 0, 0, 0); o = __builtin_amdgcn_mfma_f32_16x16x32_bf16(F.at[1], v1, o, 0, 0, 0); \
        { const size_t tb = (size_t)(n_) * 64 + 16 * wi + 4 * g; _Pragma("unroll") for (int r = 0; r < 4; ++r) GO[(tb + r) * BW + h * 128 + 16 * sl + c] = o[r]; } \
        _Pragma("unroll") for (int mt = 0; mt < 2; ++mt) { Sacc[mt] = Sacc[mt] * F.dl; \
            Sacc[mt] = __builtin_amdgcn_mfma_f32_16x16x32_bf16(F.kt[mt][0], v0, Sacc[mt], 0, 0, 0); Sacc[mt] = __builtin_amdgcn_mfma_f32_16x16x32_bf16(F.kt[mt][1], v1, Sacc[mt], 0, 0, 0); \
            v2u w; w.x = pk2(Sacc[mt][0], Sacc[mt][1]); w.y = pk2(Sacc[mt][2], Sacc[mt][3]); *(LAS v2u*)(ST + (cur ^ 1) * 16 * STP + c * STP + 16 * (2 * wi + mt) + 4 * g) = w; } \
        LDS_BAR(); } while (0)
    for (int n = 0; n < T / 64; n += 2) {
        gdn_load(F1, p, (n + 1) * 4 + h, off128, off64, offk, offu);
        GDN_STEP(F0, n);
        gdn_load(F0, p, ((n + 2 < T / 64) ? n + 2 : n) * 4 + h, off128, off64, offk, offu);
        GDN_STEP(F1, n + 1);
    }
#undef GDN_STEP
}

constexpr int SEQ_UOFF = 132096;
constexpr int GI_NW = 0, GI_QG = 8704, GI_AT = 17408, GI_KT = 22016, GI_SZ = 31232;
struct GdnStage { v4u r[7]; float u[4]; float dl; };
__device__ __forceinline__ void gdn_stage_load(GdnStage& Sg, const Params& p, int item, int tid, int offu) {
    const bf16* GNW = (const bf16*)(p.ws + WS_GNW) + (size_t)item * 8192; const bf16* GQG = (const bf16*)(p.ws + WS_GQG) + (size_t)item * 8192;
    const bf16* GAT = (const bf16*)(p.ws + WS_GAT) + (size_t)item * 4096; const bf16* GKT = (const bf16*)(p.ws + WS_GKT) + (size_t)item * 8192; const float* GU = (const float*)(p.ws + WS_GU) + (size_t)item * 8192;
    Sg.r[0] = *(const v4u*)(GNW + 8 * tid); Sg.r[1] = *(const v4u*)(GNW + 8 * (tid + 512)); Sg.r[2] = *(const v4u*)(GQG + 8 * tid); Sg.r[3] = *(const v4u*)(GQG + 8 * (tid + 512));
    Sg.r[4] = *(const v4u*)(GAT + 8 * tid); Sg.r[5] = *(const v4u*)(GKT + 8 * tid); Sg.r[6] = *(const v4u*)(GKT + 8 * (tid + 512));
#pragma unroll
    for (int r = 0; r < 4; ++r) Sg.u[r] = GU[offu + r * 128];
    Sg.dl = ((const float*)(p.ws + WS_GDL))[item];
}
__device__ __forceinline__ void gdn_stage_write(const GdnStage& Sg, LAS unsigned short* img, int tid) {
    { const int p0 = tid, p1 = tid + 512;
      *(LAS v4u*)(img + GI_NW + (p0 >> 4) * 136 + 8 * (p0 & 15)) = Sg.r[0]; *(LAS v4u*)(img + GI_NW + (p1 >> 4) * 136 + 8 * (p1 & 15)) = Sg.r[1];
      *(LAS v4u*)(img + GI_QG + (p0 >> 4) * 136 + 8 * (p0 & 15)) = Sg.r[2]; *(LAS v4u*)(img + GI_QG + (p1 >> 4) * 136 + 8 * (p1 & 15)) = Sg.r[3];
      *(LAS v4u*)(img + GI_AT + (p0 >> 3) * 72 + 8 * (p0 & 7)) = Sg.r[4];
      *(LAS v4u*)(img + GI_KT + (p0 >> 3) * 72 + 8 * (p0 & 7)) = Sg.r[5]; *(LAS v4u*)(img + GI_KT + (p1 >> 3) * 72 + 8 * (p1 & 7)) = Sg.r[6]; }
}
__device__ __forceinline__ void gdn_seq2(const Params& p, LAS unsigned char* lds, int wgi, int tid, int wave, int lane) {
    const int h = wgi >> 2, sl = 2 * (wgi & 3) + (wave >> 2), wi = wave & 3, g = lane >> 4, c = lane & 15;
    LAS unsigned short* IMG = (LAS unsigned short*)lds;
    LAS unsigned short* ST = (LAS unsigned short*)(lds + SEQ_UOFF + (wave >> 2) * 12288);
    LAS unsigned short* VNT = ST + 2 * 16 * STP;
    float* GO = (float*)(p.ws + WS_GO);
    const int offu = (16 * wi + 4 * g) * 128 + 16 * sl + c;
#pragma unroll
    for (int mt = 0; mt < 2; ++mt) *(LAS v2u*)(ST + c * STP + 16 * (2 * wi + mt) + 4 * g) = (v2u){0u, 0u};
    pg8::f32x4 Sacc[2] = {{0.f, 0.f, 0.f, 0.f}, {0.f, 0.f, 0.f, 0.f}};
    GdnStage A, B;
    gdn_stage_load(A, p, h, tid, offu); gdn_stage_write(A, IMG, tid);
    gdn_stage_load(B, p, 4 + h, tid, offu);
    LDS_BAR();
    constexpr int NCH = T / 64;
#define GDN_STEP2(X, Y, n_) do { const int cur = (n_) & 1; const LAS unsigned short* im = IMG + cur * GI_SZ; bf16x8_t sf[4]; \
        _Pragma("unroll") for (int ks = 0; ks < 4; ++ks) sf[ks] = *(const LAS bf16x8_t*)(ST + cur * 16 * STP + c * STP + 32 * ks + 8 * g); \
        pg8::f32x4 vn = {X.u[0], X.u[1], X.u[2], X.u[3]}; const float dl = X.dl; \
        _Pragma("unroll") for (int ks = 0; ks < 4; ++ks) vn = __builtin_amdgcn_mfma_f32_16x16x32_bf16(*(const LAS bf16x8_t*)(im + GI_NW + (16 * wi + c) * 136 + 32 * ks + 8 * g), sf[ks], vn, 0, 0, 0); \
        { v2u w; w.x = pk2(vn[0], vn[1]); w.y = pk2(vn[2], vn[3]); *(LAS v2u*)(VNT + c * VNP + 16 * wi + 4 * g) = w; } \
        pg8::f32x4 o = {0.f, 0.f, 0.f, 0.f}; \
        _Pragma("unroll") for (int ks = 0; ks < 4; ++ks) o = __builtin_amdgcn_mfma_f32_16x16x32_bf16(*(const LAS bf16x8_t*)(im + GI_QG + (16 * wi + c) * 136 + 32 * ks + 8 * g), sf[ks], o, 0, 0, 0); \
        LDS_BAR(); \
        gdn_stage_load(X, p, (((n_) + 2 < NCH) ? (n_) + 2 : (n_)) * 4 + h, tid, offu); \
        const bf16x8_t v0 = *(const LAS bf16x8_t*)(VNT + c * VNP + 8 * g), v1 = *(const LAS bf16x8_t*)(VNT + c * VNP + 32 + 8 * g); \
        o = __builtin_amdgcn_mfma_f32_16x16x32_bf16(*(const LAS bf16x8_t*)(im + GI_AT + (16 * wi + c) * 72 + 8 * g), v0, o, 0, 0, 0); \
        o = __builtin_amdgcn_mfma_f32_16x16x32_bf16(*(const LAS bf16x8_t*)(im + GI_AT + (16 * wi + c) * 72 + 32 + 8 * g), v1, o, 0, 0, 0); \
        { const size_t tb = (size_t)(n_) * 64 + 16 * wi + 4 * g; _Pragma("unroll") for (int r = 0; r < 4; ++r) GO[(tb + r) * BW + h * 128 + 16 * sl + c] = o[r]; } \
        _Pragma("unroll") for (int mt = 0; mt < 2; ++mt) { Sacc[mt] = Sacc[mt] * dl; \
            Sacc[mt] = __builtin_amdgcn_mfma_f32_16x16x32_bf16(*(const LAS bf16x8_t*)(im + GI_KT + (16 * (2 * wi + mt) + c) * 72 + 8 * g), v0, Sacc[mt], 0, 0, 0); \
            Sacc[mt] = __builtin_amdgcn_mfma_f32_16x16x32_bf16(*(const LAS bf16x8_t*)(im + GI_KT + (16 * (2 * wi + mt) + c) * 72 + 32 + 8 * g), v1, Sacc[mt], 0, 0, 0); \
            v2u w; w.x = pk2(Sacc[mt][0], Sacc[mt][1]); w.y = pk2(Sacc[mt][2], Sacc[mt][3]); *(LAS v2u*)(ST + (cur ^ 1) * 16 * STP + c * STP + 16 * (2 * wi + mt) + 4 * g) = w; } \
        gdn_stage_write(Y, IMG + (cur ^ 1) * GI_SZ, tid); \
        LDS_BAR(); } while (0)
    for (int n = 0; n < NCH; n += 2) { GDN_STEP2(A, B, n); GDN_STEP2(B, A, n + 1); }
#undef GDN_STEP2
}
constexpr int MI_Q = 0, MI_S = 4608, MI_K = 9216, MI_SZ = 13824;
struct MlStage { v4u r[3]; bf16x8_t vt[2]; float fl; };
__device__ __forceinline__ void ml_stage_load(MlStage& Sg, const Params& p, int item, int tid, int offV) {
    const bf16* MQ = (const bf16*)(p.ws + WS_MQ) + (size_t)item * 4096; const bf16* MS = (const bf16*)(p.ws + WS_MS) + (size_t)item * 4096; const bf16* MK = (const bf16*)(p.ws + WS_MK) + (size_t)item * 4096;
    const bf16* MV = (const bf16*)(p.ws + WS_MV) + (size_t)item * 9216;
    Sg.r[0] = *(const v4u*)(MQ + 8 * tid); Sg.r[1] = *(const v4u*)(MS + 8 * tid); Sg.r[2] = *(const v4u*)(MK + 8 * tid);
    Sg.vt[0] = *(const bf16x8_t*)(MV + offV); Sg.vt[1] = *(const bf16x8_t*)(MV + offV + 32);
    Sg.fl = ((const float*)(p.ws + WS_MFL))[item];
}
__device__ __forceinline__ void ml_stage_write(const MlStage& Sg, LAS unsigned short* img, int tid) {
    const int o = (tid >> 3) * 72 + 8 * (tid & 7);
    *(LAS v4u*)(img + MI_Q + o) = Sg.r[0]; *(LAS v4u*)(img + MI_S + o) = Sg.r[1]; *(LAS v4u*)(img + MI_K + o) = Sg.r[2];
}
__device__ __forceinline__ void ml_seq2(const Params& p, LAS unsigned char* lds, int wgi, int tid, int wave, int lane) {
    const int h = wgi / 5, sl0 = 2 * (wgi % 5) + (wave >> 2), wi = wave & 3, g = lane >> 4, c = lane & 15;
    const bool real = sl0 < 9; const int sl = real ? sl0 : 8;
    LAS unsigned short* IMG = (LAS unsigned short*)lds;
    LAS unsigned short* CT = (LAS unsigned short*)(lds + SEQ_UOFF + (wave >> 2) * 8192);
    float* HO = (float*)(p.ws + WS_HO); float* HDEN = (float*)(p.ws + WS_HDEN);
    const int offV = (16 * sl + c) * 64 + 8 * g;
    *(LAS v2u*)(CT + c * 72 + 16 * wi + 4 * g) = (v2u){0u, 0u};
    pg8::f32x4 Cacc = {0.f, 0.f, 0.f, 0.f};
    MlStage A, B;
    ml_stage_load(A, p, h, tid, offV); ml_stage_write(A, IMG, tid);
    ml_stage_load(B, p, 4 + h, tid, offV);
    LDS_BAR();
    constexpr int NCH = T / 64;
#define ML_STEP2(X, Y, n_) do { const int cur = (n_) & 1; const LAS unsigned short* im = IMG + cur * MI_SZ; const int ro = (16 * wi + c) * 72 + 8 * g; \
        const bf16x8_t c0 = *(const LAS bf16x8_t*)(CT + cur * 16 * 72 + c * 72 + 8 * g), c1 = *(const LAS bf16x8_t*)(CT + cur * 16 * 72 + c * 72 + 32 + 8 * g); \
        const bf16x8_t vt0 = X.vt[0], vt1 = X.vt[1]; const float fl = X.fl; \
        pg8::f32x4 num = {0.f, 0.f, 0.f, 0.f}; \
        num = __builtin_amdgcn_mfma_f32_16x16x32_bf16(*(const LAS bf16x8_t*)(im + MI_Q + ro), c0, num, 0, 0, 0); num = __builtin_amdgcn_mfma_f32_16x16x32_bf16(*(const LAS bf16x8_t*)(im + MI_Q + ro + 32), c1, num, 0, 0, 0); \
        num = __builtin_amdgcn_mfma_f32_16x16x32_bf16(*(const LAS bf16x8_t*)(im + MI_S + ro), vt0, num, 0, 0, 0); num = __builtin_amdgcn_mfma_f32_16x16x32_bf16(*(const LAS bf16x8_t*)(im + MI_S + ro + 32), vt1, num, 0, 0, 0); \
        Cacc = Cacc * fl; \
        Cacc = __builtin_amdgcn_mfma_f32_16x16x32_bf16(*(const LAS bf16x8_t*)(im + MI_K + ro), vt0, Cacc, 0, 0, 0); Cacc = __builtin_amdgcn_mfma_f32_16x16x32_bf16(*(const LAS bf16x8_t*)(im + MI_K + ro + 32), vt1, Cacc, 0, 0, 0); \
        ml_stage_load(X, p, (((n_) + 2 < NCH) ? (n_) + 2 : (n_)) * 4 + h, tid, offV); \
        { v2u w; w.x = pk2(Cacc[0], Cacc[1]); w.y = pk2(Cacc[2], Cacc[3]); *(LAS v2u*)(CT + (cur ^ 1) * 16 * 72 + c * 72 + 16 * wi + 4 * g) = w; } \
        { const size_t tb = (size_t)(n_) * 64 + 16 * wi + 4 * g; \
          if (sl < 8) { _Pragma("unroll") for (int r = 0; r < 4; ++r) HO[(tb + r) * BW + h * 128 + 16 * sl + c] = num[r]; } \
          else if (c == 0 && real) { _Pragma("unroll") for (int r = 0; r < 4; ++r) HDEN[(tb + r) * 4 + h] = num[r]; } } \
        ml_stage_write(Y, IMG + (cur ^ 1) * MI_SZ, tid); \
        LDS_BAR(); } while (0)
    for (int n = 0; n < NCH; n += 2) { ML_STEP2(A, B, n); ML_STEP2(B, A, n + 1); }
#undef ML_STEP2
}

__device__ __forceinline__ void mixer_gmlp_item(const Params& p, int l, LAS unsigned char* lds, int item, int tid, int wave, int lane) {
    const int chunk = item >> 2, g = item & 3; const size_t tok0 = (size_t)chunk * 128;
    const bf16* Z = (const bf16*)(p.ws + WS_Z); bf16* BR1 = (bf16*)(p.ws + WS_BR) + 1 * BW;
    const float* ng = p.in[I_GMNG] + l * BW; const float* nb = p.in[I_GMNB] + l * BW;
    const float* wsp = p.in[I_GMWS] + ((size_t)(l * 4 + g) * 128) * 128; const float* bsp = p.in[I_GMBS] + (l * 4 + g) * 128;
    LAS float* vn = (LAS float*)lds;
    for (int r = 0; r < 16; ++r) { const int tk = wave * 16 + r;
        const v4u raw = *(const v4u*)(Z + (tok0 + tk) * ZC + ZC_GMV + 8 * lane); float x[8]; unpack8(raw, x); float s = 0.f;
#pragma unroll
        for (int i = 0; i < 8; ++i) { x[i] = gelu_tanh(x[i]); s += x[i]; }
        const float mean = wave_sum(s) * (1.f / 512.f); float ss = 0.f;
#pragma unroll
        for (int i = 0; i < 8; ++i) { x[i] -= mean; ss += x[i] * x[i]; }
        const float rstd = rsqrtf(wave_sum(ss) * (1.f / 512.f) + LN_EPS);
        if ((lane >> 4) == g) { const int cl = 8 * (lane & 15);
#pragma unroll
            for (int i = 0; i < 8; ++i) vn[tk * 128 + cl + i] = x[i] * rstd * ng[8 * lane + i] + nb[8 * lane + i]; }
    }
    __syncthreads();
    const int t = tid >> 2, cq = tid & 3; float acc[32];
#pragma unroll
    for (int i = 0; i < 32; ++i) acc[i] = 0.f;
    const float* wrow = wsp + (size_t)t * 128;
    for (int s = 0; s <= t; ++s) { const float w = wrow[s]; const LAS float* row = vn + s * 128 + cq * 32;
#pragma unroll
        for (int i4 = 0; i4 < 8; ++i4) { const v4f a = *(const LAS v4f*)(row + 4 * i4); acc[4 * i4] += w * a.x; acc[4 * i4 + 1] += w * a.y; acc[4 * i4 + 2] += w * a.z; acc[4 * i4 + 3] += w * a.w; } }
    const float bias = bsp[t];
#pragma unroll
    for (int i8 = 0; i8 < 4; ++i8) { const v4u raw = *(const v4u*)(Z + (tok0 + t) * ZC + ZC_GMU + g * 128 + cq * 32 + 8 * i8); float u[8]; unpack8(raw, u); float o[8];
#pragma unroll
        for (int i = 0; i < 8; ++i) o[i] = gelu_tanh(u[i]) * (acc[8 * i8 + i] + bias);
        v4u w; w.x = pk2(o[0], o[1]); w.y = pk2(o[2], o[3]); w.z = pk2(o[4], o[5]); w.w = pk2(o[6], o[7]);
        *(v4u*)(BR1 + (tok0 + t) * BRW + g * 128 + cq * 32 + 8 * i8) = w; }
    __syncthreads();
}

__device__ __forceinline__ void vt_item(const Params& p, LAS unsigned char* lds, int item, int tid) {
    const int h = item & 3, n = item >> 2; const size_t t0 = (size_t)n * 64;
    const bf16* Z = (const bf16*)(p.ws + WS_Z); bf16* VT = (bf16*)(p.ws + WS_VT);
    LAS unsigned short* vs = (LAS unsigned short*)lds;
#pragma unroll
    for (int r = 0; r < 2; ++r) { const int idx = tid + 512 * r, tk = idx >> 4, c8 = idx & 15;
        *(LAS v4u*)(vs + tk * 136 + 8 * c8) = *(const v4u*)(Z + (t0 + tk) * ZC + ZC_SBV + h * 128 + 8 * c8); }
    __syncthreads();
    { const int d = tid >> 2, jq = tid & 3; unsigned w[8];
#pragma unroll
      for (int x = 0; x < 8; ++x) w[x] = (unsigned)vs[(16 * jq + 2 * x) * 136 + d] | ((unsigned)vs[(16 * jq + 2 * x + 1) * 136 + d] << 16);
      bf16* dst = VT + ((size_t)h * 128 + d) * T + t0 + 16 * jq;
      *(v4u*)dst = (v4u){w[0], w[1], w[2], w[3]}; *(v4u*)(dst + 8) = (v4u){w[4], w[5], w[6], w[7]}; }
    __syncthreads();
}
constexpr int KTP = 136, VTP = 72;
__device__ __forceinline__ void sb_unit(const Params& p, LAS unsigned char* lds, int unit, int tid, int wave, int lane) {
    const int h = unit >> 6, q0 = (unit & 63) * 128, g = lane >> 4, c = lane & 15; const int qrow = q0 + 16 * wave + c;
    const bf16* Z = (const bf16*)(p.ws + WS_Z); const bf16* VT = (const bf16*)(p.ws + WS_VT) + (size_t)h * 128 * T; bf16* BR0 = (bf16*)(p.ws + WS_BR);
    LAS unsigned short* Kt = (LAS unsigned short*)lds;
    LAS unsigned short* Vt = Kt + 2 * 64 * KTP;
    LAS int* flags = (LAS int*)(Vt + 2 * 128 * VTP);
    bf16x8_t qf[4];
#pragma unroll
    for (int ks = 0; ks < 4; ++ks) qf[ks] = *(const bf16x8_t*)(Z + (size_t)qrow * ZC + ZC_SBQ + h * 128 + 32 * ks + 8 * g);
    pg8::f32x4 acc[8];
#pragma unroll
    for (int dt = 0; dt < 8; ++dt) acc[dt] = (pg8::f32x4){0.f, 0.f, 0.f, 0.f};
    float racc = 0.f;
    v4u kr[2], vr[2];
    const int jt = (q0 >> 6) + 1;
#define SB_GLOAD(j_) do { _Pragma("unroll") for (int r = 0; r < 2; ++r) { const int idx = tid + 512 * r; \
        kr[r] = *(const v4u*)(Z + (size_t)(64 * (j_) + (idx >> 4)) * ZC + ZC_SBK + h * 128 + 8 * (idx & 15)); \
        vr[r] = *(const v4u*)(VT + (size_t)(idx >> 3) * T + 64 * (j_) + 8 * (idx & 7)); } } while (0)
#define SB_LWRITE(b_) do { _Pragma("unroll") for (int r = 0; r < 2; ++r) { const int idx = tid + 512 * r; \
        *(LAS v4u*)(Kt + (b_) * 64 * KTP + (idx >> 4) * KTP + 8 * (idx & 15)) = kr[r]; *(LAS v4u*)(Vt + (b_) * 128 * VTP + (idx >> 3) * VTP + 8 * (idx & 7)) = vr[r]; } } while (0)
    LDS_BAR();
    SB_GLOAD(jt); SB_LWRITE(0);
    LDS_BAR();
    for (int j = jt, it = 0; j >= 0; --j, ++it) {
        const int cur = it & 1;
        SB_GLOAD(j > 0 ? j - 1 : 0);
        const bool wdone = __all(racc > 104.f);
        if (64 * j < q0 + 16 * wave + 15 && !wdone) {
            const LAS unsigned short* Kc = Kt + cur * 64 * KTP; const LAS unsigned short* Vc = Vt + cur * 128 * VTP;
            pg8::f32x4 z[4];
#pragma unroll
            for (int s = 0; s < 4; ++s) { z[s] = (pg8::f32x4){0.f, 0.f, 0.f, 0.f};
#pragma unroll
                for (int ks = 0; ks < 4; ++ks) z[s] = __builtin_amdgcn_mfma_f32_16x16x32_bf16(*(const LAS bf16x8_t*)(Kc + (16 * s + c) * KTP + 32 * ks + 8 * g), qf[ks], z[s], 0, 0, 0); }
            float sp[4][4], t[4], xs[4]; bool mk[4][4];
#pragma unroll
            for (int s = 0; s < 4; ++s) { t[s] = 0.f;
#pragma unroll
                for (int r = 0; r < 4; ++r) { const int key = 64 * j + 16 * s + 4 * g + r; mk[s][r] = key < qrow; const float zz = z[s][r] * 0.08838834764831845f; z[s][r] = zz;
                    sp[s][r] = mk[s][r] ? softplusf_(zz) : 0.f; t[s] += sp[s][r]; } }
            float grand = 0.f, higher[4];
#pragma unroll
            for (int s = 3; s >= 0; --s) { float x = t[s]; float y = __shfl(x, lane + 16); x += (g < 3) ? y : 0.f; y = __shfl(x, lane + 32); x += (g < 2) ? y : 0.f;
                xs[s] = x - t[s];
                const float tot = __shfl(x, c); higher[s] = grand; grand += tot; }
            bf16x8_t pf[2];
#pragma unroll
            for (int s = 0; s < 4; ++s) { float a[4]; float e = 0.f;
#pragma unroll
                for (int r = 3; r >= 0; --r) { const float la = z[s][r] - sp[s][r] - (racc + higher[s] + xs[s] + e); a[r] = mk[s][r] ? __expf(la) : 0.f; e += sp[s][r]; }
                const unsigned w0 = pk2(a[0], a[1]), w1 = pk2(a[2], a[3]);
                if ((s & 1) == 0) { pf[s >> 1][0] = (short)(w0 & 0xffff); pf[s >> 1][1] = (short)(w0 >> 16); pf[s >> 1][2] = (short)(w1 & 0xffff); pf[s >> 1][3] = (short)(w1 >> 16); }
                else              { pf[s >> 1][4] = (short)(w0 & 0xffff); pf[s >> 1][5] = (short)(w0 >> 16); pf[s >> 1][6] = (short)(w1 & 0xffff); pf[s >> 1][7] = (short)(w1 >> 16); } }
            racc += grand;
#pragma unroll
            for (int dt = 0; dt < 8; ++dt)
#pragma unroll
                for (int k2 = 0; k2 < 2; ++k2) { const v2u lo = *(const LAS v2u*)(Vc + (16 * dt + c) * VTP + 32 * k2 + 4 * g), hi = *(const LAS v2u*)(Vc + (16 * dt + c) * VTP + 32 * k2 + 16 + 4 * g);
                    const v4u vv = (v4u){lo.x, lo.y, hi.x, hi.y};
                    acc[dt] = __builtin_amdgcn_mfma_f32_16x16x32_bf16(__builtin_bit_cast(bf16x8_t, vv), pf[k2], acc[dt], 0, 0, 0); }
        }
        const bool wd2 = __all(racc > 104.f);
        if (lane == 0) flags[cur * 8 + wave] = wd2 ? 1 : 0;
        SB_LWRITE(cur ^ 1);
        LDS_BAR();
        int alld = 1;
#pragma unroll
        for (int w = 0; w < 8; ++w) alld &= flags[cur * 8 + w];
        if (alld) break;
    }
#undef SB_GLOAD
#undef SB_LWRITE
#pragma unroll
    for (int dt = 0; dt < 8; ++dt) { v2u w; w.x = pk2(acc[dt][0], acc[dt][1]); w.y = pk2(acc[dt][2], acc[dt][3]); *(v2u*)(BR0 + (size_t)qrow * BRW + h * 128 + 16 * dt + 4 * g) = w; }
}

__device__ __forceinline__ void phase_mixers(const Params& p, int l, LAS unsigned char* lds, int wg, int G, int tid, int wave, int lane, const XcdBarrier& bar) {
#if defined(PROBE_SPLIT)
    if (wg < 16) gdn_seq2(p, lds, wg, tid, wave, lane); else if (wg < 36) ml_seq2(p, lds, wg - 16, tid, wave, lane);
    xcd_barrier(bar);
    const int w2 = wg, G2 = G;
#else
    if (wg < 16) { gdn_seq2(p, lds, wg, tid, wave, lane); return; }
    if (wg < 36) { ml_seq2(p, lds, wg - 16, tid, wave, lane); return; }
    const int w2 = wg - 36, G2 = G - 36;
#endif
    for (int it = w2; it < 256; it += G2) mixer_gmlp_item(p, l, lds, it, tid, wave, lane);
    for (int it = w2; it < 256; it += G2) sb_unit(p, lds, it, tid, wave, lane);
#if !defined(PROBE_CONV0)
    __syncthreads();
#if defined(PROBE_CONVDUP)
#pragma nounroll
    for (int rep = 0; rep < 2; ++rep)
#endif
    phase_convert<1>(p, l, lds, w2 * 8 + wave, G2 * 8, wave, lane);
#endif
}

__device__ __forceinline__ void phase_post(const Params& p, int l, int gw, int NGW, int lane) {
    const bf16* Z = (const bf16*)(p.ws + WS_Z); const float* GO = (const float*)(p.ws + WS_GO); const float* HO = (const float*)(p.ws + WS_HO); const float* HDEN = (const float*)(p.ws + WS_HDEN);
    bf16* BR2 = (bf16*)(p.ws + WS_BR) + 2 * BW; bf16* BR3 = (bf16*)(p.ws + WS_BR) + 3 * BW;
    const float* gng = p.in[I_GDNNG] + l * 128; const float* mng = p.in[I_MLNG] + l * BW;
    for (int t = gw; t < T; t += NGW) {
        {   const v4f a0 = *(const v4f*)(GO + (size_t)t * BW + 8 * lane), a1 = *(const v4f*)(GO + (size_t)t * BW + 8 * lane + 4); float o[8] = {a0.x, a0.y, a0.z, a0.w, a1.x, a1.y, a1.z, a1.w}; float ss = 0.f;
#pragma unroll
            for (int i = 0; i < 8; ++i) ss += o[i] * o[i];
            const float r = rsqrtf(sum16(ss) * (1.f / 128.f) + LN_EPS);
            const v4u graw = *(const v4u*)(Z + (size_t)t * ZC + ZC_GDNG + 8 * lane); float gt[8]; unpack8(graw, gt);
#pragma unroll
            for (int i = 0; i < 8; ++i) o[i] = o[i] * r * gng[(8 * lane + i) & 127] * siluf_(gt[i]);
            v4u w; w.x = pk2(o[0], o[1]); w.y = pk2(o[2], o[3]); w.z = pk2(o[4], o[5]); w.w = pk2(o[6], o[7]); *(v4u*)(BR2 + (size_t)t * BRW + 8 * lane) = w; }
        {   const v4f a0 = *(const v4f*)(HO + (size_t)t * BW + 8 * lane), a1 = *(const v4f*)(HO + (size_t)t * BW + 8 * lane + 4); float o[8] = {a0.x, a0.y, a0.z, a0.w, a1.x, a1.y, a1.z, a1.w}; float ss = 0.f;
            const float dn = 1.f / fmaxf(fabsf(HDEN[(size_t)t * 4 + (lane >> 4)]), 1.f);
#pragma unroll
            for (int i = 0; i < 8; ++i) { o[i] *= dn; ss += o[i] * o[i]; }
            const float r = rsqrtf(sum16(ss) * (1.f / 128.f) + LN_EPS);
            const v4u graw = *(const v4u*)(Z + (size_t)t * ZC + ZC_MLO + 8 * lane); float gt[8]; unpack8(graw, gt);
#pragma unroll
            for (int i = 0; i < 8; ++i) o[i] = o[i] * r * mng[8 * lane + i] * sigmoidf_(gt[i]);
            v4u w; w.x = pk2(o[0], o[1]); w.y = pk2(o[2], o[3]); w.z = pk2(o[4], o[5]); w.w = pk2(o[6], o[7]); *(v4u*)(BR3 + (size_t)t * BRW + 8 * lane) = w; }
    }
}

__device__ __forceinline__ void ln_row(const float* yrow, const float* g, const float* b, int lane, v4f (&v)[8]) {
    const v4f* yr = (const v4f*)yrow + lane; float s = 0.f;
#pragma unroll
    for (int j = 0; j < 8; ++j) { v[j] = yr[64 * j]; s += (v[j].x + v[j].y) + (v[j].z + v[j].w); }
    const float mean = wave_sum(s) * (1.f / D); float s2 = 0.f;
#pragma unroll
    for (int j = 0; j < 8; ++j) { v[j] = v[j] - mean; s2 += (v[j].x * v[j].x + v[j].y * v[j].y) + (v[j].z * v[j].z + v[j].w * v[j].w); }
    const float rstd = rsqrtf(wave_sum(s2) * (1.f / D) + LN_EPS);
#pragma unroll
    for (int j = 0; j < 8; ++j) { const v4f gg = ((const v4f*)g)[lane + 64 * j], bb = ((const v4f*)b)[lane + 64 * j]; v[j] = v[j] * rstd * gg + bb; }
}
constexpr int RT_XP = 2052;
constexpr int RT_TAB = 131072 + 1024;
__device__ __forceinline__ void phase_ln1_router(const Params& p, int l, LAS unsigned char* lds, int wg, int G, int wave, int lane, int cnt_shift = 0) {
    const float* Y = (const float*)(p.ws + WS_Y); float* X1 = (float*)(p.ws + WS_X1); bf16* X1B = (bf16*)(p.ws + WS_X1B); int* LIST = (int*)(p.ws + WS_LIST); float* WL = (float*)(p.ws + WS_WL); unsigned* SLOT = (unsigned*)(p.ws + WS_SLOT);
    unsigned* cnt = (unsigned*)(p.ws + WS_CTL) + CW_CNT + l * 4096 + cnt_shift;
    const float* g1 = p.in[I_LN1G] + (size_t)l * D; const float* b1 = p.in[I_LN1B] + (size_t)l * D;
    const float* wr = p.in[I_WR] + (size_t)l * D * NE; const float rbias = p.in[I_RB][l * NE + lane];
    LAS float* xt = (LAS float*)lds;
    LAS float* part = (LAS float*)lds;
    LAS unsigned char* selm = lds + RT_TAB; LAS unsigned char* rkm = selm + 4096; LAS float* wtm = (LAS float*)(rkm + 4096); LAS unsigned* basem = (LAS unsigned*)(wtm + 4096);
    const int n_l = lane & 15, kq = lane >> 4;
    int gi = 0;
    for (int tg = wg; tg < T / 16; tg += G, ++gi) {
        {   v4f va[8], vb[8]; const size_t m0 = (size_t)tg * 16 + 2 * wave;
            const v4f* ya = (const v4f*)(Y + m0 * D) + lane; const v4f* yb = (const v4f*)(Y + (m0 + 1) * D) + lane;
#pragma unroll
            for (int j = 0; j < 8; ++j) { va[j] = ya[64 * j]; vb[j] = yb[64 * j]; }
            float sa = 0.f, sb = 0.f;
#pragma unroll
            for (int j = 0; j < 8; ++j) { sa += (va[j].x + va[j].y) + (va[j].z + va[j].w); sb += (vb[j].x + vb[j].y) + (vb[j].z + vb[j].w); }
            const float ma = wave_sum(sa) * (1.f / D), mb = wave_sum(sb) * (1.f / D); float qa = 0.f, qb = 0.f;
#pragma unroll
            for (int j = 0; j < 8; ++j) { va[j] = va[j] - ma; vb[j] = vb[j] - mb; qa += (va[j].x * va[j].x + va[j].y * va[j].y) + (va[j].z * va[j].z + va[j].w * va[j].w); qb += (vb[j].x * vb[j].x + vb[j].y * vb[j].y) + (vb[j].z * vb[j].z + vb[j].w * vb[j].w); }
            const float ra = rsqrtf(wave_sum(qa) * (1.f / D) + LN_EPS), rb = rsqrtf(wave_sum(qb) * (1.f / D) + LN_EPS);
#pragma unroll
            for (int j = 0; j < 8; ++j) { const v4f gg = ((const v4f*)g1)[lane + 64 * j], bb = ((const v4f*)b1)[lane + 64 * j]; va[j] = va[j] * ra * gg + bb; vb[j] = vb[j] * rb * gg + bb; }
#pragma unroll
            for (int rr = 0; rr < 2; ++rr) { const size_t m = m0 + rr; v4f* xo = (v4f*)(X1 + m * D) + lane;
#pragma unroll
                for (int j = 0; j < 8; ++j) { const v4f v = rr ? vb[j] : va[j]; xo[64 * j] = v;
#if MOE_UP_FP8
                    { unsigned w = 0; w = __builtin_amdgcn_cvt_pk_fp8_f32(v.x, v.y, w, false); w = __builtin_amdgcn_cvt_pk_fp8_f32(v.z, v.w, w, true); ((unsigned*)((unsigned char*)X1B + m * D))[lane + 64 * j] = w; }
#else
                    { v2u o; o.x = pk2(v.x, v.y); o.y = pk2(v.z, v.w); ((v2u*)(X1B + m * D))[lane + 64 * j] = o; }
#endif
                    *(LAS v4f*)(xt + (2 * wave + rr) * RT_XP + 4 * lane + 256 * j) = v; } } }
        __syncthreads();
        {   pg8::f32x4 acc[4];
#pragma unroll
            for (int i = 0; i < 4; ++i) acc[i] = (pg8::f32x4){0.f, 0.f, 0.f, 0.f};
            const float* wb = wr + (size_t)(256 * wave + 4 * kq) * NE + 4 * n_l;
            const LAS float* xa = xt + n_l * RT_XP + 256 * wave + 4 * kq;
            v4f bwa[16], bwb[16];
#define RT_LOADW(dst, sb_) do { _Pragma("unroll") for (int q = 0; q < 16; ++q) dst[q] = *(const v4f*)(wb + (size_t)(16 * (4 * (sb_) + (q >> 2)) + (q & 3)) * NE); } while (0)
#define RT_MMA(src, sb_) do { _Pragma("unroll") for (int sg = 0; sg < 4; ++sg) { const v4f a4 = *(const LAS v4f*)(xa + 16 * (4 * (sb_) + sg)); \
                _Pragma("unroll") for (int c = 0; c < 4; ++c) { const v4f b4 = src[sg * 4 + c]; const float a = c == 0 ? a4.x : c == 1 ? a4.y : c == 2 ? a4.z : a4.w; \
                    acc[0] = __builtin_amdgcn_mfma_f32_16x16x4f32(a, b4.x, acc[0], 0, 0, 0); acc[1] = __builtin_amdgcn_mfma_f32_16x16x4f32(a, b4.y, acc[1], 0, 0, 0); \
                    acc[2] = __builtin_amdgcn_mfma_f32_16x16x4f32(a, b4.z, acc[2], 0, 0, 0); acc[3] = __builtin_amdgcn_mfma_f32_16x16x4f32(a, b4.w, acc[3], 0, 0, 0); } } } while (0)
            RT_LOADW(bwa, 0);
#pragma unroll 1
            for (int h = 0; h < 2; ++h) {
                RT_LOADW(bwb, 1); RT_MMA(bwa, 0);
                if (h == 0) RT_LOADW(bwa, 2);
                RT_MMA(bwb, 1);
                wb += (size_t)128 * NE; xa += 128; asm volatile("" : "+v"(wb));
            }
#undef RT_LOADW
#undef RT_MMA
            __syncthreads();
#pragma unroll
            for (int j = 0; j < 4; ++j) *(LAS v4f*)(part + (wave * 16 + 4 * kq + j) * 64 + 4 * n_l) = (v4f){acc[0][j], acc[1][j], acc[2][j], acc[3][j]}; }
        __syncthreads();
#pragma unroll 1
        for (int rr = 0; rr < 2; ++rr) { const int lr = wave + 8 * rr; float logit = 0.f;
#pragma unroll
            for (int w = 0; w < 8; ++w) logit += part[(w * 16 + lr) * 64 + lane];
            const float s = sigmoidf_(logit), biased = s + rbias;
            const float m1 = max8(biased); const float li = (float)(lane & 7);
            const float first = min8(biased == m1 ? li : 8.f);
            const float m2 = max8(li == first ? -INFINITY : biased);
            const float gs = m1 + m2; const int myg = lane >> 3; int grank = 0;
#pragma unroll
            for (int g2 = 0; g2 < 8; ++g2) { const float o = __builtin_bit_cast(float, __builtin_amdgcn_readlane(__builtin_bit_cast(int, gs), g2 * 8)); grank += (o > gs || (o == gs && g2 < myg)) ? 1 : 0; }
            const float masked = grank < 4 ? biased : -INFINITY; int rank = 0;
#pragma unroll
            for (int e2 = 0; e2 < 64; ++e2) { const float o = __builtin_bit_cast(float, __builtin_amdgcn_readlane(__builtin_bit_cast(int, masked), e2)); rank += (o > masked || (o == masked && e2 < lane)) ? 1 : 0; }
            const float wsel = rank < 6 ? s : 0.f; const float tot = wave_sum(wsel);
            const int ri = gi * 16 + lr;
            selm[ri * 64 + lane] = (rank < 6) ? 1 : 0; rkm[ri * 64 + lane] = (unsigned char)rank; wtm[ri * 64 + lane] = wsel / tot * 2.5f; }
        __syncthreads();
    }
    const int nrows = gi * 16;
    if (wave == 0) { unsigned n = 0;
        for (int r = 0; r < nrows; ++r) n += selm[r * 64 + lane];
        unsigned base = 0; if (n && !(PROBE_NOATOM && cnt_shift)) base = __hip_atomic_fetch_add(cnt + 64 * lane, n, __ATOMIC_RELAXED, __HIP_MEMORY_SCOPE_AGENT);
        basem[lane] = base; }
    __syncthreads();
    for (int ri = wave; ri < nrows; ri += 8) { unsigned pos = basem[lane];
        for (int r = 0; r < ri; ++r) pos += selm[r * 64 + lane];
        if (selm[ri * 64 + lane]) { const size_t m = (size_t)(wg + (ri >> 4) * G) * 16 + (ri & 15); const int rk = rkm[ri * 64 + lane];
            LIST[lane * T + pos] = (int)m; WL[lane * T + pos] = wtm[ri * 64 + lane]; SLOT[m * 8 + rk] = ((unsigned)lane << 16) | pos; } }
    __syncthreads();
}
__device__ __forceinline__ void phase_combine_ln2(const Params& p, int l, float* dst, int gw, int NGW, int lane) {
    const float* X1 = (const float*)(p.ws + WS_X1); const bf16* YE = (const bf16*)(p.ws + WS_YEXP); const unsigned* SLOT = (const unsigned*)(p.ws + WS_SLOT);
    const unsigned* cnt = (const unsigned*)(p.ws + WS_CTL) + CW_CNT + l * 4096;
    const float* g2 = p.in[I_LN2G] + (size_t)l * D; const float* b2 = p.in[I_LN2B] + (size_t)l * D;
    const int tiles = ((int)cnt[64 * lane] + 255) >> 8; const float incl = wave_scan_incl((float)tiles);
    const int toff = (int)incl - tiles;
    const int tsh = __builtin_amdgcn_readlane((int)incl, 63);
    for (int m = gw; m < T; m += NGW) {
        v4f v[8]; const v4f* xr = (const v4f*)(X1 + (size_t)m * D) + lane;
#pragma unroll
        for (int j = 0; j < 8; ++j) v[j] = xr[64 * j] * ALPHA;
#pragma unroll
        for (int k = 0; k < 7; ++k) { size_t row;
            if (k == 0) row = (size_t)tsh * 256 + m;
            else { const unsigned s = __builtin_amdgcn_readfirstlane(SLOT[(size_t)m * 8 + (k - 1)]); const int e = (int)(s >> 16); row = (size_t)__builtin_amdgcn_readlane(toff, e) * 256 + (s & 0xffffu); }
            const v2u* yr = (const v2u*)(YE + row * D) + lane;
#pragma unroll
            for (int j = 0; j < 8; ++j) { const v2u y = yr[64 * j]; v[j].x += bflo(y.x); v[j].y += bfhi(y.x); v[j].z += bflo(y.y); v[j].w += bfhi(y.y); } }
        float s = 0.f;
#pragma unroll
        for (int j = 0; j < 8; ++j) s += (v[j].x + v[j].y) + (v[j].z + v[j].w);
        const float mean = wave_sum(s) * (1.f / D); float s2 = 0.f;
#pragma unroll
        for (int j = 0; j < 8; ++j) { v[j] = v[j] - mean; s2 += (v[j].x * v[j].x + v[j].y * v[j].y) + (v[j].z * v[j].z + v[j].w * v[j].w); }
        const float rstd = rsqrtf(wave_sum(s2) * (1.f / D) + LN_EPS);
        v4f* xo = (v4f*)(dst + (size_t)m * D) + lane;
#pragma unroll
        for (int j = 0; j < 8; ++j) { const v4f gg = ((const v4f*)g2)[lane + 64 * j], bb = ((const v4f*)b2)[lane + 64 * j]; xo[64 * j] = v[j] * rstd * gg + bb; }
    }
}

constexpr int NPH = 11;
template <class S> struct DupOrder {
    S s; int n;
    __device__ __forceinline__ bool next(int i, Unit& u) const { return s.next(i >= n ? i - n : i, u); }
    __device__ __forceinline__ int row_token(int i, int r) const { return s.row_token(i >= n ? i - n : i, r); }
    __device__ __forceinline__ void a_ready(const Unit& u) const { s.a_ready(u); }
    __device__ __forceinline__ void done(const Unit& u) const { s.done(u); }
};
template <class S> __device__ __forceinline__ int count_units(const S& s) { Unit u; int n = 0; while (n < 64 && s.next(n, u)) ++n; return n; }
#define ORDER_T(k, T) typename std::conditional<PROBE_DUP == (k), DupOrder<T>, T>::type
template <class S> __device__ __forceinline__ DupOrder<S> make_order(const S& s, std::true_type) { DupOrder<S> d{s, count_units(s)}; d.n = count_units(s); return d; }
template <class S> __device__ __forceinline__ S make_order(const S& s, std::false_type) { return s; }
#define MAKE_ORDER(k, s) make_order(s, std::integral_constant<bool, PROBE_DUP == (k)>())
template <int l>
__device__ __forceinline__ void run_layer(const Params& p, LAS unsigned char* lds, const XcdBarrier& bar, int tid, int lane, int wave, int G, int wg, int gw, int NGW) {
    unsigned char* ws = p.ws;
    {
        const float* xin = (l == 0) ? p.in[I_X] : (const float*)(ws + WS_XCUR);
        float* xout = (l == NL - 1) ? p.out : (float*)(ws + WS_XCUR);
#ifndef PROBE_DUP
#define PROBE_DUP (-1)
#endif
#define IS_GEMM_PH(k) ((k) == 1 || (k) == 5 || (k) == 6 || (k) == 8 || (k) == 9)
#define REP(k) _Pragma("nounroll") for (int _r = 0; _r < ((PROBE_DUP == (k) && !IS_GEMM_PH(k)) ? 2 + (p.ph_lo >> 20) : 1); ++_r)
#ifndef PH_MASK
#define PH_MASK 0x7ff
#endif
#define RUN(k) (((PH_MASK >> (k)) & 1) && p.ph_lo <= l * NPH + (k) && l * NPH + (k) < p.ph_hi)
#define SEAM(k) do { if (l * NPH + (k) + 1 < p.ph_hi) xcd_barrier(bar); } while (0)
        if (RUN(0)) { REP(0) { phase_convert<0>(p, l, lds, gw, NGW, wave, lane);
#if defined(PROBE_CONV0)
            phase_convert<1>(p, l, lds, gw, NGW, wave, lane);
#endif
 phase_xprep(p, l, xin, lds, gw, NGW, tid, lane); } SEAM(0); }
        if (RUN(1)) { REP(1) { pg8::Gemm g{(const bf16*)(ws + WS_XB), (const bf16*)(ws + WS_WIN), T, ZC, D / 2, D / 2, D / 2}; pg8::StaticOrder S; S.init(T, ZC, G, wg);
            pg8::EpiBf16<0> E{(bf16*)(ws + WS_Z), ZC, nullptr, 0, 0, 1.f / 64.f};
            auto S2 = MAKE_ORDER(1, S); pg8::gemm_phase<pg8::EpiBf16<0>, ORDER_T(1, pg8::StaticOrder), true, true, true>(lds, g, S2, E); } SEAM(1); }
        if (RUN(2)) { REP(2) { for (int it = wg; it < 1536; it += G) { if (it < 512) gdn_pre_item(p, l, lds, it, tid, wave, lane); else if (it < 1024) ml_pre_item(p, l, lds, it - 512, tid, wave, lane); else vt_item(p, lds, it - 1024, tid); } } SEAM(2); }
        if (RUN(3)) { REP(3) { phase_mixers(p, l, lds, wg, G, tid, wave, lane, bar); } SEAM(3); }
        if (RUN(4)) { REP(4) { phase_post(p, l, gw, NGW, lane); } SEAM(4); }
        if (RUN(5)) { REP(5) { pg8::Gemm g{(const bf16*)(ws + WS_BR), (const bf16*)(ws + WS_WBR), T, D, BRW, BRW, BRW}; pg8::StaticOrder S; S.init(T, D, G, wg);
            EpiMergeH E{(const bf16*)(ws + WS_Z), (bf16*)(ws + WS_MSUM)};
            auto S2 = MAKE_ORDER(5, S); pg8::gemm_phase<EpiMergeH, ORDER_T(5, pg8::StaticOrder), true, true>(lds, g, S2, E); } SEAM(5); }
        if (RUN(6)) { REP(6) { pg8::Gemm g{(const bf16*)(ws + WS_MSUM), (const bf16*)(ws + WS_WOUT), T, D, D / 2, D / 2, D / 2}; pg8::StaticOrder S; S.init(T, D, G, wg);
            EpiResid E{xin, (float*)(ws + WS_Y), 1.f / 64.f};
            auto S2 = MAKE_ORDER(6, S); pg8::gemm_phase<EpiResid, ORDER_T(6, pg8::StaticOrder), true, true, true>(lds, g, S2, E); } SEAM(6); }
        if (RUN(7)) { REP(7) { phase_ln1_router(p, l, lds, wg, G, wave, lane, (PROBE_DUP == 7 && _r == 0) ? 16384 : 0); } SEAM(7); }
        if (RUN(8)) { REP(8) { const unsigned* cnt = (const unsigned*)(ws + WS_CTL) + CW_CNT + l * 4096; MoeTab M(lds); moe_tables(M, cnt, tid, lane, wave);
            UpOrder S{M, 0}; S.n = up_order_build(M, (const int*)(ws + WS_LIST), (const float*)(ws + WS_WL), wg, G, tid);
            constexpr int KU = MOE_UP_FP8 ? D / 2 : D;
            pg8::Gemm g{(const bf16*)(ws + WS_X1B), (const bf16*)(ws + WS_WUP), T, NEX * 1024, KU, KU, KU};
            EpiGluSparse E{(LAS const float*)M.wt, (bf16*)(ws + WS_HB)};
            auto S2 = MAKE_ORDER(8, S); pg8::gemm_phase_gather<EpiGluSparse, ORDER_T(8, UpOrder), MOE_UP_FP8 != 0>(lds, g, S2, E); } SEAM(8); }
        if (RUN(9)) { REP(9) { const unsigned* cnt = (const unsigned*)(ws + WS_CTL) + CW_CNT + l * 4096; MoeTab M(lds); moe_tables(M, cnt, tid, lane, wave);
            DownOrder S{M, G, wg, 8 * M.t[65]};
            pg8::Gemm g{(const bf16*)(ws + WS_HB), (const bf16*)(ws + WS_WDN), HROWS, NEX * D, ED, ED, ED};
            EpiYexp E{(bf16*)(ws + WS_YEXP)};
            auto S2 = MAKE_ORDER(9, S); pg8::gemm_phase<EpiYexp, ORDER_T(9, DownOrder), true, true>(lds, g, S2, E); } SEAM(9); }
        if (RUN(10)) { REP(10) { phase_combine_ln2(p, l, xout, gw, NGW, lane); } SEAM(10); }
#undef RUN
#undef SEAM
    }
}
__global__ void __launch_bounds__(512, 2) fwd_kernel(Params p) {
    extern __shared__ __attribute__((aligned(16))) unsigned char lds_raw[];
    LAS unsigned char* lds = (LAS unsigned char*)lds_raw;
    const int tid = threadIdx.x, lane = tid & 63, wave = __builtin_amdgcn_readfirstlane(tid >> 6);
    const int G = gridDim.x, wg = blockIdx.x, gw = wg * 8 + wave, NGW = G * 8;
    volatile LAS unsigned* MISC = (volatile LAS unsigned*)(lds + MISC_OFF);
    if (tid < 32) MISC[tid] = 0u;
    __syncthreads();
    unsigned* ctl = (unsigned*)(p.ws + WS_CTL);
    const bool multi = (p.ph_hi - p.ph_lo) > 1;
    XcdBarrier bar; bar.bar = ctl + CW_BAR; bar.x = 0; bar.st = nullptr;
    if (multi) bar = xcd_barrier_post(ctl + CW_BAR, MISC + 8);
    run_layer<0>(p, lds, bar, tid, lane, wave, G, wg, gw, NGW);
    run_layer<1>(p, lds, bar, tid, lane, wave, G, wg, gw, NGW);
}

#ifndef MK_MULTI_LAUNCH
#define MK_MULTI_LAUNCH 0
#endif
extern "C" void kernel_launch(void* const* d_in, const int* in_sizes, int n_in, void* d_out, int out_size, void* d_ws, size_t ws_size, hipStream_t stream) {
    static int grid = 0;
    if (grid == 0) {
        if (n_in != 27 || out_size != T * D || ws_size < WS_END) { fprintf(stderr, "kernel_launch: unexpected shapes (n_in %d out %d ws %zu need %zu)\n", n_in, out_size, ws_size, (size_t)WS_END); grid = -1; return; }
        int dev = 0, cus = 0, per_cu = 0;
        if (hipGetDevice(&dev) != hipSuccess || hipDeviceGetAttribute(&cus, hipDeviceAttributeMultiprocessorCount, dev) != hipSuccess) { grid = -1; return; }
        if (hipFuncSetAttribute((const void*)fwd_kernel, hipFuncAttributeMaxDynamicSharedMemorySize, LDS_BYTES) != hipSuccess) { fprintf(stderr, "kernel_launch: hipFuncSetAttribute failed\n"); grid = -1; return; }
        if (hipOccupancyMaxActiveBlocksPerMultiprocessor(&per_cu, (const void*)fwd_kernel, 512, LDS_BYTES) != hipSuccess || per_cu < 1) { fprintf(stderr, "kernel_launch: occupancy query says %d\n", per_cu); }
        (void)hipGetLastError();
        grid = cus;
    }
    if (grid < 0) return;
    (void)hipMemsetAsync((char*)d_ws + WS_CTL, 0, CTL_ZERO_BYTES, stream);
    Params p{};
    for (int i = 0; i < 27; ++i) p.in[i] = (const float*)d_in[i];
    p.out = (float*)d_out; p.ws = (unsigned char*)d_ws;
#if MK_MULTI_LAUNCH
    for (int ph = 0; ph < NL * NPH; ++ph) { p.ph_lo = ph; p.ph_hi = ph + 1; hipLaunchKernelGGL(fwd_kernel, dim3(grid), dim3(512), LDS_BYTES, stream, p); }
#else
    p.ph_lo = 0; p.ph_hi = NL * NPH; hipLaunchKernelGGL(fwd_kernel, dim3(grid), dim3(512), LDS_BYTES, stream, p);
#endif
}
```

```cpp
#include <hip/hip_runtime.h>
#include <cstdio>
#include <cstdint>
#include <type_traits>
namespace pg8 {
#define PG8_LAS __attribute__((address_space(3)))
typedef unsigned short bf16_t;
typedef short bf16x8 __attribute__((ext_vector_type(8)));
typedef float f32x4 __attribute__((ext_vector_type(4)));
typedef unsigned u32x4 __attribute__((ext_vector_type(4)));
constexpr int BM = 256, BK = 64, HALF = 128, HTB = HALF * BK * 2  , STAGE_BYTES = 8 * HTB, NXCD = 8, WGM = 8;

__host__ __device__ __forceinline__ int lds_byte(int r, int c) { const int st = (r >> 4) * 2 + (c >> 5), rr = r & 15, cc = c & 31, ob = rr * 64 + cc * 2; return st * 1024 + (ob ^ (((ob >> 9) & 1) << 5)); }
__host__ __device__ __forceinline__ void stage_rc(int b, int& R, int& C) { const int st = b / 1024, sb = b % 1024, swz = sb ^ (((sb >> 9) & 1) << 5); R = (st >> 1) * 16 + swz / 64; C = (st & 1) * 32 + (swz % 64) / 2; }
__host__ __device__ __forceinline__ int perm32(int rho) { const int n = rho >> 4, i = rho & 15; return 8 * (i >> 2) + 4 * n + (i & 3); }

struct Unit { int pm, pn, aux; };
struct Gemm { const bf16_t* A; const bf16_t* Bt; int M, N, K, lda, ldb; };

struct StaticOrder {
    int nM, nN, nwg, G, c;
    __host__ __device__ void init(int M, int N, int G_, int c_) { nM = M / BM; nN = N / BM; nwg = nM * nN; G = G_; c = c_; }
    __host__ __device__ bool next(int i, Unit& u) const {
        const long L = (long)i * G + c; if (L >= nwg) return false;
        int wgid = (int)L; { const int q = nwg / NXCD, r = nwg % NXCD, xcd = wgid % NXCD, off = wgid / NXCD; wgid = (xcd < r ? xcd * (q + 1) : r * (q + 1) + (xcd - r) * q) + off; }
        const int nig = WGM * nN, gid = wgid / nig, fm = gid * WGM, gsz = (nM - fm) < WGM ? (nM - fm) : WGM;
        u.pm = fm + ((wgid % nig) % gsz); u.pn = (wgid % nig) / gsz; return true;
    }
    __device__ __forceinline__ void a_ready(const Unit&) const {}
    __device__ __forceinline__ void done(const Unit&) const {}
};

__device__ __forceinline__ unsigned cvt_pk_bf16(float lo, float hi) { unsigned r; asm volatile("v_cvt_pk_bf16_f32 %0, %1, %2" : "=v"(r) : "v"(lo), "v"(hi)); return r; }
typedef float f32x2 __attribute__((ext_vector_type(2)));
__device__ __forceinline__ f32x2 gelu_pk(f32x2 v) {
    const f32x2 av = __builtin_elementwise_abs(v), d = av * 0.2316418882f + 1.0f;
    f32x2 t; t.x = __builtin_amdgcn_rcpf(d.x); t.y = __builtin_amdgcn_rcpf(d.y);
    f32x2 q = t * 0.5307027145f + (-0.7265760135f); q = q * t + 0.7107068705f; q = q * t + (-0.142248368f); q = q * t + 0.127414796f; q = q * t;
    const f32x2 s = (v * v) * (-0.72134752044f);
    f32x2 e; e.x = __builtin_amdgcn_exp2f(s.x); e.y = __builtin_amdgcn_exp2f(s.y);
    const f32x2 m = v * (q * e), r = v - m;
    f32x2 o; o.x = v.x < 0.f ? m.x : r.x; o.y = v.y < 0.f ? m.y : r.y; return o;
}

template <int ACT  > struct EpiBf16 {
    static constexpr bool PERM = true, AFTER_DRAIN = false; static constexpr int MID = 0; static_assert(ACT == 0 || ACT == 1, "EpiBf16: ACT is 0 (none) or 1 (gelu_pk)");
    bf16_t* O; int ldc; const float* bias; int split_cols; size_t split_stride; float scale0;
    __device__ __forceinline__ void operator()(const f32x4 (&acc)[2][2][4][2], const Unit& u, int wr, int wc, int fr, int fq) const {
        const int row0 = u.pm * BM + wr * 64 + fr; int colt = u.pn * BM; bf16_t* base = O;
        float sc = scale0; if (split_cols) { const int t = colt / split_cols; base += (size_t)t * split_stride; colt -= t * split_cols; if (t != 0) sc = 1.f; }
        const int col0 = colt + wc * 32 + 8 * fq, bcol0 = u.pn * BM + wc * 32 + 8 * fq;
        f32x4 bv[2][2];
#pragma unroll
        for (int bj = 0; bj < 2; ++bj)
#pragma unroll
            for (int n = 0; n < 2; ++n) bv[bj][n] = bias ? *(const f32x4*)(bias + bcol0 + bj * HALF + 4 * n) : (f32x4){0.f, 0.f, 0.f, 0.f};
#pragma unroll
        for (int ai = 0; ai < 2; ++ai)
#pragma unroll
            for (int m = 0; m < 4; ++m) { bf16_t* rowp = base + (size_t)(row0 + ai * HALF + m * 16) * ldc + col0;
#pragma unroll
                for (int bj = 0; bj < 2; ++bj) { f32x4 v0 = acc[ai][bj][m][0] + bv[bj][0], v1 = acc[ai][bj][m][1] + bv[bj][1];
                    if (ACT == 1) { f32x2 a = gelu_pk((f32x2){v0[0], v0[1]}), b = gelu_pk((f32x2){v0[2], v0[3]}), c = gelu_pk((f32x2){v1[0], v1[1]}), d = gelu_pk((f32x2){v1[2], v1[3]});
                        v0 = (f32x4){a.x, a.y, b.x, b.y}; v1 = (f32x4){c.x, c.y, d.x, d.y}; }
                    v0 = v0 * sc; v1 = v1 * sc; u32x4 w; w.x = cvt_pk_bf16(v0[0], v0[1]); w.y = cvt_pk_bf16(v0[2], v0[3]); w.z = cvt_pk_bf16(v1[0], v1[1]); w.w = cvt_pk_bf16(v1[2], v1[3]);
                    *(u32x4*)(rowp + bj * HALF) = w; } }
    }
};

typedef int i32x8 __attribute__((ext_vector_type(8)));
__device__ __forceinline__ i32x8 cat8(const bf16x8 a, const bf16x8 b) { typedef int i32x4 __attribute__((ext_vector_type(4))); const i32x4 x = __builtin_bit_cast(i32x4, a), y = __builtin_bit_cast(i32x4, b); return (i32x8){x[0], x[1], x[2], x[3], y[0], y[1], y[2], y[3]}; }
__device__ __forceinline__ bf16x8 lo8(const i32x8 v) { typedef int i32x4 __attribute__((ext_vector_type(4))); return __builtin_bit_cast(bf16x8, __builtin_shufflevector(v, v, 0, 1, 2, 3)); }
__device__ __forceinline__ bf16x8 hi8(const i32x8 v) { typedef int i32x4 __attribute__((ext_vector_type(4))); return __builtin_bit_cast(bf16x8, __builtin_shufflevector(v, v, 4, 5, 6, 7)); }
template <class Epi, class Sched, bool ALIGN_EPI = false, bool SP2 = false, bool FP8 = false>
__device__ __forceinline__ void gemm_phase(PG8_LAS unsigned char* lds, const Gemm g, const Sched& S, const Epi& E) {
    const int tid = threadIdx.x, wid = __builtin_amdgcn_readfirstlane(tid >> 6), lane = tid & 63, wr = wid >> 2, wc = wid & 3, fr = lane & 15, fq = lane >> 4;
    const int K = g.K, nt = K / BK;
    unsigned voffA[2], voffB[2];
#pragma unroll
    for (int i = 0; i < 2; ++i) { int R, C; stage_rc(tid * 16 + i * 8192, R, C); const int Rb = Epi::PERM ? ((R & ~31) + perm32(R & 31)) : R;
        voffA[i] = (unsigned)(R * g.lda + C) * 2u; voffB[i] = (unsigned)(Rb * g.ldb + C) * 2u; }
    const size_t kstep = (size_t)(BK * 2);
    const size_t hstepA = (size_t)HALF * g.lda * 2, hstepB = (size_t)HALF * g.ldb * 2;
    const size_t tstepA = 2 * hstepA, tstepB = 2 * hstepB;
    const unsigned ldsw = (unsigned)wid * 1024u;
    const int aoff = lds_byte(wr * 64 + fr, fq * 8), boff = lds_byte(wc * 32 + fr, fq * 8);
#define PG8_SA(b, h) (((b) * 2 + (h)) * HTB)
#define PG8_SB(b, h) ((4 + (b) * 2 + (h)) * HTB)
#define PG8_STAGE(bufoff, gbase, voff) do { _Pragma("unroll") for (int _i = 0; _i < 2; ++_i) \
        __builtin_amdgcn_global_load_lds((const unsigned*)((const char*)(gbase) + (voff)[_i]), (PG8_LAS unsigned*)(lds + (bufoff) + ldsw + _i * 8192), 16, 0, 0); } while (0)
#define PG8_LDA(dst, b, h) do { _Pragma("unroll") for (int m = 0; m < 4; ++m) { if constexpr (FP8) dst##8[m] = cat8(*(const PG8_LAS bf16x8*)(lds + PG8_SA(b, h) + aoff + m * 2048), *(const PG8_LAS bf16x8*)(lds + PG8_SA(b, h) + aoff + m * 2048 + 1024)); \
        else { _Pragma("unroll") for (int k = 0; k < 2; ++k) dst[m][k] = *(const PG8_LAS bf16x8*)(lds + PG8_SA(b, h) + aoff + m * 2048 + k * 1024); } } } while (0)
#define PG8_LDB(dst, b, h) do { _Pragma("unroll") for (int n = 0; n < 2; ++n) { if constexpr (FP8) dst##8[n] = cat8(*(const PG8_LAS bf16x8*)(lds + PG8_SB(b, h) + boff + n * 2048), *(const PG8_LAS bf16x8*)(lds + PG8_SB(b, h) + boff + n * 2048 + 1024)); \
        else { _Pragma("unroll") for (int k = 0; k < 2; ++k) dst[n][k] = *(const PG8_LAS bf16x8*)(lds + PG8_SB(b, h) + boff + n * 2048 + k * 1024); } } } while (0)
#define PG8_MMA(ai, bj, At, Bt) do { __builtin_amdgcn_s_setprio(1); _Pragma("unroll") for (int m = 0; m < 4; ++m) _Pragma("unroll") for (int n = 0; n < 2; ++n) { \
        if constexpr (FP8) asm volatile("v_mfma_scale_f32_16x16x128_f8f6f4 %0, %1, %2, %0, %3, %3 op_sel_hi:[0,0,0]" : "+v"(acc[ai][bj][m][n]) : "v"(Bt##8[n]), "v"(At##8[m]), "v"(fp8_unit_scale)); \
        else { _Pragma("unroll") for (int k = 0; k < 2; ++k) acc[ai][bj][m][n] = __builtin_amdgcn_mfma_f32_16x16x32_bf16(Bt[n][k], At[m][k], acc[ai][bj][m][n], 0, 0, 0); } } __builtin_amdgcn_s_setprio(0); } while (0)
#define PG8_WAIT_V(n) asm volatile("s_waitcnt vmcnt(" #n ")" ::: "memory")
#define PG8_WAIT_L(n) asm volatile("s_waitcnt lgkmcnt(" #n ")" ::: "memory")
#define PG8_BAR __builtin_amdgcn_s_barrier()
#define PG8_SCHED __builtin_amdgcn_sched_barrier(0)
    Unit cur, nxt; int ui = 0;
    if (!S.next(0, cur)) return;
    f32x4 acc[2][2][4][2];
#pragma unroll
    for (int a = 0; a < 2; ++a)
#pragma unroll
        for (int b = 0; b < 2; ++b)
#pragma unroll
            for (int m = 0; m < 4; ++m)
#pragma unroll
                for (int n = 0; n < 2; ++n) acc[a][b][m][n] = (f32x4){0.f, 0.f, 0.f, 0.f};
    int fp8_unit_scale = 0x7F7F7F7F; asm volatile("" : "+v"(fp8_unit_scale));
    bf16x8 At[4][2], B0[2][2], B1[2][2];
    i32x8 At8[4], B08[2], B18[2];
    const char* cA = (const char*)g.A + (size_t)cur.pm * tstepA; const char* cB = (const char*)g.Bt + (size_t)cur.pn * tstepB;
    S.a_ready(cur);
    if constexpr (SP2) {
        PG8_STAGE(PG8_SB(0, 0), cB, voffB); PG8_STAGE(PG8_SB(0, 1), cB + hstepB, voffB); PG8_STAGE(PG8_SA(0, 0), cA, voffA); PG8_STAGE(PG8_SA(0, 1), cA + hstepA, voffA);
        if (wr == 1) PG8_BAR;
        PG8_WAIT_V(2); PG8_BAR;
        PG8_STAGE(PG8_SB(1, 0), cB + kstep, voffB); PG8_STAGE(PG8_SA(1, 0), cA + kstep, voffA); PG8_STAGE(PG8_SB(1, 1), cB + hstepB + kstep, voffB);
        PG8_WAIT_V(6); PG8_BAR;
    } else {
        PG8_STAGE(PG8_SB(0, 0), cB, voffB); PG8_STAGE(PG8_SA(0, 0), cA, voffA); PG8_STAGE(PG8_SB(0, 1), cB + hstepB, voffB); PG8_STAGE(PG8_SA(0, 1), cA + hstepA, voffA);
        if (wr == 1) PG8_BAR;
        PG8_WAIT_V(4); PG8_BAR;
        PG8_STAGE(PG8_SB(1, 0), cB + kstep, voffB); PG8_STAGE(PG8_SA(1, 0), cA + kstep, voffA); PG8_STAGE(PG8_SB(1, 1), cB + hstepB + kstep, voffB);
        PG8_WAIT_V(6); PG8_BAR;
    }
    for (;;) {
        const bool has_next = S.next(ui + 1, nxt);
        const char* nA = has_next ? (const char*)g.A + (size_t)nxt.pm * tstepA : cA; const char* nB = has_next ? (const char*)g.Bt + (size_t)nxt.pn * tstepB : cB;
        for (int t = 0; t < nt; t += 2) {
            const bool last = (t == nt - 2);
            const char* a1 = cA + (size_t)(t + 1) * kstep;
            const char* a2 = last ? nA : cA + (size_t)(t + 2) * kstep; const char* b2 = last ? nB : cB + (size_t)(t + 2) * kstep;
            const char* a3 = a2 + kstep; const char* b3 = b2 + kstep;
            if (last && has_next) S.a_ready(nxt);
            if constexpr (SP2) {
            if constexpr (Epi::MID > 0) { if (t != 0 && (t % Epi::MID) == 0) { PG8_SCHED; E.mid(acc, cur, t / Epi::MID, wr, wc, fr, fq); PG8_SCHED; } }
            PG8_LDB(B0, 0, 0); PG8_LDB(B1, 0, 1); PG8_SCHED; PG8_LDA(At, 0, 0); PG8_STAGE(PG8_SA(1, 1), a1 + hstepA, voffA);
            PG8_WAIT_V(8); PG8_WAIT_L(0); PG8_BAR; PG8_MMA(0, 0, At, B0); PG8_MMA(0, 1, At, B1); PG8_BAR; PG8_SCHED;
            PG8_LDA(At, 0, 1); PG8_STAGE(PG8_SB(0, 0), b2, voffB); PG8_STAGE(PG8_SB(0, 1), b2 + hstepB, voffB); PG8_STAGE(PG8_SA(0, 0), a2, voffA);
            PG8_WAIT_V(8); PG8_WAIT_L(0); PG8_BAR; PG8_MMA(1, 0, At, B0); PG8_MMA(1, 1, At, B1); PG8_BAR; PG8_SCHED;
            PG8_LDB(B0, 1, 0); PG8_LDB(B1, 1, 1); PG8_SCHED; PG8_LDA(At, 1, 0); PG8_STAGE(PG8_SA(0, 1), a2 + hstepA, voffA);
            PG8_WAIT_V(8); PG8_WAIT_L(0); PG8_BAR; PG8_MMA(0, 0, At, B0); PG8_MMA(0, 1, At, B1); PG8_BAR; PG8_SCHED;
            PG8_LDA(At, 1, 1); PG8_STAGE(PG8_SB(1, 0), b3, voffB); PG8_STAGE(PG8_SB(1, 1), b3 + hstepB, voffB); PG8_STAGE(PG8_SA(1, 0), a3, voffA);
            PG8_WAIT_V(8); PG8_WAIT_L(0); PG8_BAR; PG8_MMA(1, 0, At, B0); PG8_MMA(1, 1, At, B1); PG8_BAR; PG8_SCHED;
            } else {
            PG8_LDB(B0, 0, 0); PG8_SCHED; PG8_LDA(At, 0, 0); PG8_STAGE(PG8_SA(1, 1), a1 + hstepA, voffA);
            PG8_WAIT_L(8); PG8_BAR; PG8_WAIT_L(0); PG8_MMA(0, 0, At, B0); PG8_BAR; PG8_SCHED;
            PG8_LDB(B1, 0, 1); PG8_STAGE(PG8_SB(0, 0), b2, voffB);
            PG8_BAR; PG8_WAIT_L(0); PG8_MMA(0, 1, At, B1); PG8_BAR;
            PG8_LDA(At, 0, 1); PG8_STAGE(PG8_SA(0, 0), a2, voffA);
            PG8_BAR; PG8_WAIT_L(0); PG8_MMA(1, 0, At, B0); PG8_BAR; PG8_SCHED;
            PG8_STAGE(PG8_SB(0, 1), b2 + hstepB, voffB);
            PG8_WAIT_V(6); PG8_BAR; PG8_MMA(1, 1, At, B1); PG8_BAR;
            PG8_LDB(B0, 1, 0); PG8_SCHED; PG8_LDA(At, 1, 0); PG8_STAGE(PG8_SA(0, 1), a2 + hstepA, voffA);
            PG8_WAIT_L(8); PG8_BAR; PG8_WAIT_L(0); PG8_MMA(0, 0, At, B0); PG8_BAR; PG8_SCHED;
            PG8_LDB(B1, 1, 1); PG8_STAGE(PG8_SB(1, 0), b3, voffB);
            PG8_BAR; PG8_WAIT_L(0); PG8_MMA(0, 1, At, B1); PG8_BAR;
            PG8_LDA(At, 1, 1); PG8_STAGE(PG8_SA(1, 0), a3, voffA);
            PG8_BAR; PG8_WAIT_L(0); PG8_MMA(1, 0, At, B0); PG8_BAR; PG8_SCHED;
            PG8_STAGE(PG8_SB(1, 1), b3 + hstepB, voffB);
            PG8_WAIT_V(6); PG8_BAR; PG8_MMA(1, 1, At, B1); PG8_BAR;
            }
        }
        if constexpr (ALIGN_EPI) { if (wr == 0) PG8_BAR; }
        if constexpr (FP8) asm volatile("s_nop 7\n\ts_nop 7" ::: "memory");
        if constexpr (!Epi::AFTER_DRAIN) { E(acc, cur, wr, wc, fr, fq); S.done(cur); }
        if (!has_next) break;
#pragma unroll
        for (int a = 0; a < 2; ++a)
#pragma unroll
            for (int b = 0; b < 2; ++b)
#pragma unroll
                for (int m = 0; m < 4; ++m)
#pragma unroll
                    for (int n = 0; n < 2; ++n) acc[a][b][m][n] = (f32x4){0.f, 0.f, 0.f, 0.f};
        cur = nxt; cA = nA; cB = nB; ++ui;
        if constexpr (ALIGN_EPI) { if (wr == 1) PG8_BAR; }
    }
    PG8_WAIT_V(0);
    if constexpr (!ALIGN_EPI) { if (wr == 0) PG8_BAR; }
    PG8_BAR;
    if constexpr (Epi::AFTER_DRAIN) { E.fused(acc, cur, wr, wc, fr, fq, lds, wid, lane); S.done(cur); }
#undef PG8_SA
#undef PG8_SB
#undef PG8_STAGE
#undef PG8_LDA
#undef PG8_LDB
#undef PG8_MMA
#undef PG8_WAIT_V
#undef PG8_WAIT_L
#undef PG8_BAR
#undef PG8_SCHED
}
template <class Epi, class Sched, bool FP8 = false>
__device__ __forceinline__ void gemm_phase_gather(PG8_LAS unsigned char* lds, const Gemm g, const Sched& S, const Epi& E) {
    const int tid = threadIdx.x, wid = __builtin_amdgcn_readfirstlane(tid >> 6), lane = tid & 63, wr = wid >> 2, wc = wid & 3, fr = lane & 15, fq = lane >> 4;
    const int K = g.K, nt = K / BK;
    unsigned voffB[2]; int RA[2], CA[2];
#pragma unroll
    for (int i = 0; i < 2; ++i) { int R, C; stage_rc(tid * 16 + i * 8192, R, C); const int Rb = Epi::PERM ? ((R & ~31) + perm32(R & 31)) : R;
        RA[i] = R; CA[i] = C; voffB[i] = (unsigned)(Rb * g.ldb + C) * 2u; }
    const size_t kstep = (size_t)(BK * 2);
    const size_t hstepB = (size_t)HALF * g.ldb * 2, tstepB = 2 * hstepB;
    const unsigned ldsw = (unsigned)wid * 1024u;
    const int aoff = lds_byte(wr * 64 + fr, fq * 8), boff = lds_byte(wc * 32 + fr, fq * 8);
#define PG8_SA(b, h) (((b) * 2 + (h)) * HTB)
#define PG8_SB(b, h) ((4 + (b) * 2 + (h)) * HTB)
#define PG8_STAGE(bufoff, gbase, voff) do { _Pragma("unroll") for (int _i = 0; _i < 2; ++_i) \
        __builtin_amdgcn_global_load_lds((const unsigned*)((const char*)(gbase) + (voff)[_i]), (PG8_LAS unsigned*)(lds + (bufoff) + ldsw + _i * 8192), 16, 0, 0); } while (0)
#define PG8_LDA(dst, b, h) do { _Pragma("unroll") for (int m = 0; m < 4; ++m) { if constexpr (FP8) dst##8[m] = cat8(*(const PG8_LAS bf16x8*)(lds + PG8_SA(b, h) + aoff + m * 2048), *(const PG8_LAS bf16x8*)(lds + PG8_SA(b, h) + aoff + m * 2048 + 1024)); \
        else { _Pragma("unroll") for (int k = 0; k < 2; ++k) dst[m][k] = *(const PG8_LAS bf16x8*)(lds + PG8_SA(b, h) + aoff + m * 2048 + k * 1024); } } } while (0)
#define PG8_LDB(dst, b, h) do { _Pragma("unroll") for (int n = 0; n < 2; ++n) { if constexpr (FP8) dst##8[n] = cat8(*(const PG8_LAS bf16x8*)(lds + PG8_SB(b, h) + boff + n * 2048), *(const PG8_LAS bf16x8*)(lds + PG8_SB(b, h) + boff + n * 2048 + 1024)); \
        else { _Pragma("unroll") for (int k = 0; k < 2; ++k) dst[n][k] = *(const PG8_LAS bf16x8*)(lds + PG8_SB(b, h) + boff + n * 2048 + k * 1024); } } } while (0)
#define PG8_MMA(ai, bj, At, Bt) do { __builtin_amdgcn_s_setprio(1); _Pragma("unroll") for (int m = 0; m < 4; ++m) _Pragma("unroll") for (int n = 0; n < 2; ++n) { \
        if constexpr (FP8) asm volatile("v_mfma_scale_f32_16x16x128_f8f6f4 %0, %1, %2, %0, %3, %3 op_sel_hi:[0,0,0]" : "+v"(acc[ai][bj][m][n]) : "v"(Bt##8[n]), "v"(At##8[m]), "v"(fp8_unit_scale)); \
        else { _Pragma("unroll") for (int k = 0; k < 2; ++k) acc[ai][bj][m][n] = __builtin_amdgcn_mfma_f32_16x16x32_bf16(Bt[n][k], At[m][k], acc[ai][bj][m][n], 0, 0, 0); } } __builtin_amdgcn_s_setprio(0); } while (0)
#define PG8_WAIT_V(n) asm volatile("s_waitcnt vmcnt(" #n ")" ::: "memory")
#define PG8_WAIT_L(n) asm volatile("s_waitcnt lgkmcnt(" #n ")" ::: "memory")
#define PG8_BAR __builtin_amdgcn_s_barrier()
#define PG8_SCHED __builtin_amdgcn_sched_barrier(0)
#define PG8_ROWS(dst, ui_) do { _Pragma("unroll") for (int _h = 0; _h < 2; ++_h) _Pragma("unroll") for (int _i = 0; _i < 2; ++_i) \
        dst[_h][_i] = (unsigned)S.row_token((ui_), _h * HALF + RA[_i]) * (unsigned)(g.lda * 2) + (unsigned)(CA[_i] * 2); } while (0)
    Unit cur, nxt; int ui = 0;
    if (!S.next(0, cur)) return;
    f32x4 acc[2][2][4][2];
#pragma unroll
    for (int a = 0; a < 2; ++a)
#pragma unroll
        for (int b = 0; b < 2; ++b)
#pragma unroll
            for (int m = 0; m < 4; ++m)
#pragma unroll
                for (int n = 0; n < 2; ++n) acc[a][b][m][n] = (f32x4){0.f, 0.f, 0.f, 0.f};
    int fp8_unit_scale = 0x7F7F7F7F; asm volatile("" : "+v"(fp8_unit_scale));
    bf16x8 At[4][2], B0[2][2], B1[2][2];
    i32x8 At8[4], B08[2], B18[2];
    unsigned offC[2][2];
    PG8_ROWS(offC, 0);
    const char* gA = (const char*)g.A;
    const char* cB = (const char*)g.Bt + (size_t)cur.pn * tstepB;
    PG8_STAGE(PG8_SB(0, 0), cB, voffB); PG8_STAGE(PG8_SB(0, 1), cB + hstepB, voffB); PG8_STAGE(PG8_SA(0, 0), gA, offC[0]); PG8_STAGE(PG8_SA(0, 1), gA, offC[1]);
    if (wr == 1) PG8_BAR;
    PG8_WAIT_V(2); PG8_BAR;
    PG8_STAGE(PG8_SB(1, 0), cB + kstep, voffB); PG8_STAGE(PG8_SA(1, 0), gA + kstep, offC[0]); PG8_STAGE(PG8_SB(1, 1), cB + hstepB + kstep, voffB);
    PG8_WAIT_V(6); PG8_BAR;
    for (;;) {
        const bool has_next = S.next(ui + 1, nxt);
        const char* nB = has_next ? (const char*)g.Bt + (size_t)nxt.pn * tstepB : cB;
        for (int t = 0; t < nt; t += 2) {
            const bool last = (t == nt - 2);
            const char* a1 = gA + (size_t)(t + 1) * kstep;
            const char* a2 = last ? gA : gA + (size_t)(t + 2) * kstep; const char* b2 = last ? nB : cB + (size_t)(t + 2) * kstep;
            const char* a3 = a2 + kstep; const char* b3 = b2 + kstep;
            PG8_LDB(B0, 0, 0); PG8_LDB(B1, 0, 1); PG8_SCHED; PG8_LDA(At, 0, 0); PG8_STAGE(PG8_SA(1, 1), a1, offC[1]);
            if (last && has_next) { PG8_ROWS(offC, ui + 1); }
            PG8_WAIT_V(8); PG8_WAIT_L(0); PG8_BAR; PG8_MMA(0, 0, At, B0); PG8_MMA(0, 1, At, B1); PG8_BAR; PG8_SCHED;
            PG8_LDA(At, 0, 1); PG8_STAGE(PG8_SB(0, 0), b2, voffB); PG8_STAGE(PG8_SB(0, 1), b2 + hstepB, voffB); PG8_STAGE(PG8_SA(0, 0), a2, offC[0]);
            PG8_WAIT_V(8); PG8_WAIT_L(0); PG8_BAR; PG8_MMA(1, 0, At, B0); PG8_MMA(1, 1, At, B1); PG8_BAR; PG8_SCHED;
            PG8_LDB(B0, 1, 0); PG8_LDB(B1, 1, 1); PG8_SCHED; PG8_LDA(At, 1, 0); PG8_STAGE(PG8_SA(0, 1), a2, offC[1]);
            PG8_WAIT_V(8); PG8_WAIT_L(0); PG8_BAR; PG8_MMA(0, 0, At, B0); PG8_MMA(0, 1, At, B1); PG8_BAR; PG8_SCHED;
            PG8_LDA(At, 1, 1); PG8_STAGE(PG8_SB(1, 0), b3, voffB); PG8_STAGE(PG8_SB(1, 1), b3 + hstepB, voffB); PG8_STAGE(PG8_SA(1, 0), a3, offC[0]);
            PG8_WAIT_V(8); PG8_WAIT_L(0); PG8_BAR; PG8_MMA(1, 0, At, B0); PG8_MMA(1, 1, At, B1); PG8_BAR; PG8_SCHED;
        }
        if (wr == 0) PG8_BAR;
        if constexpr (FP8) asm volatile("s_nop 7\n\ts_nop 7" ::: "memory");
        E(acc, cur, wr, wc, fr, fq); S.done(cur);
        if (!has_next) break;
#pragma unroll
        for (int a = 0; a < 2; ++a)
#pragma unroll
            for (int b = 0; b < 2; ++b)
#pragma unroll
                for (int m = 0; m < 4; ++m)
#pragma unroll
                    for (int n = 0; n < 2; ++n) acc[a][b][m][n] = (f32x4){0.f, 0.f, 0.f, 0.f};
        cur = nxt; cB = nB; ++ui;
        if (wr == 1) PG8_BAR;
    }
    PG8_WAIT_V(0);
    PG8_BAR;
#undef PG8_ROWS
#undef PG8_SA
#undef PG8_SB
#undef PG8_STAGE
#undef PG8_LDA
#undef PG8_LDB
#undef PG8_MMA
#undef PG8_WAIT_V
#undef PG8_WAIT_L
#undef PG8_BAR
#undef PG8_SCHED
}
}

#ifndef MOE_DN_FP8
#define MOE_DN_FP8 1
#endif
#ifndef MOE_UP_FP8
#define MOE_UP_FP8 1
#endif
#ifndef PROBE_NOATOM
#define PROBE_NOATOM 0
#endif
constexpr int T = 8192, D = 2048, NL = 2, BW = 512, ZC = 14336, INC = 14352;
constexpr int NE = 64, NEX = 65  , ED = 512;
constexpr int BRW = 4 * BW;
constexpr int HK = NEX * ED;
constexpr float ALPHA = 1.41421356237f;
constexpr float LN_EPS = 1e-5f;
constexpr float UPSC = MOE_UP_FP8 ? (1.f / 64.f) : 1.f;
constexpr float HSC = 8.f, DNSC = MOE_DN_FP8 ? (1.f / (HSC * 64.f)) : 1.f;
constexpr int ZC_SBQ = 0, ZC_SBK = 512, ZC_SBV = 1024, ZC_GMU = 1536, ZC_GMV = 2048, ZC_GDN = 2560, ZC_GDNG = 4096,
              ZC_MLQ = 4608, ZC_MLK = 4864, ZC_MLV = 5120, ZC_MLO = 5632, ZC_GATE = 6144;

#define GAS __attribute__((address_space(1)))
#define LAS __attribute__((address_space(3)))
typedef unsigned short bf16;
typedef unsigned v4u __attribute__((ext_vector_type(4)));
typedef unsigned v2u __attribute__((ext_vector_type(2)));
typedef float v4f __attribute__((ext_vector_type(4)));
typedef float v2f __attribute__((ext_vector_type(2)));
#define LDS_WAIT() asm volatile("s_waitcnt lgkmcnt(0)" ::: "memory")
#define LDS_BAR() do { asm volatile("s_waitcnt lgkmcnt(0)" ::: "memory"); __builtin_amdgcn_s_barrier(); asm volatile("" ::: "memory"); } while (0)

constexpr size_t MiB = 1u << 20;
constexpr size_t WS_CTL = 0, CTL_ZERO_BYTES = 1 * MiB;
constexpr size_t WS_WIN = 2 * MiB, WS_WBR = 58 * MiB, WS_WOUT = 66 * MiB, WS_WUP = 74 * MiB, WS_WDN = 334 * MiB;
constexpr size_t WS_XB = 464 * MiB, WS_SMALL = 496 * MiB, WS_EG = 497 * MiB, WS_BETA = WS_EG + 256 * 1024, WS_COMB = 498 * MiB;
constexpr size_t WS_Z = 500 * MiB, WS_GQ = 724 * MiB, WS_GK = 740 * MiB, WS_GV = 756 * MiB, WS_GO = 772 * MiB, WS_HO = 788 * MiB;
constexpr size_t WS_BR = 804 * MiB, WS_MTMP = 836 * MiB, WS_MSUM = 900 * MiB, WS_Y = 932 * MiB, WS_X1 = 996 * MiB, WS_X1B = 1060 * MiB;
constexpr size_t WS_XCUR = 1092 * MiB, WS_HB = 1156 * MiB, WS_YEXP = 1236 * MiB, WS_LIST = 1524 * MiB, WS_WL = 1526 * MiB, WS_SLOT = 1528 * MiB, WS_MQ = 1530 * MiB, WS_MS = 1534 * MiB, WS_MK = 1538 * MiB, WS_MV = 1542 * MiB, WS_MFL = 1552 * MiB, WS_HDEN = WS_MFL + 65536, WS_VT = 1553 * MiB, WS_END = 1561 * MiB;
constexpr size_t WS_GU = WS_GQ, WS_GNW = WS_GK, WS_GQG = WS_GK + 8 * MiB, WS_GKT = WS_GV, WS_GAT = WS_GV + 8 * MiB, WS_GDL = WS_GV + 12 * MiB;
constexpr int HROWS = 73728;
static_assert(WS_HB + (size_t)HROWS * ED * 2 <= WS_YEXP && WS_YEXP + (size_t)HROWS * D * 2 <= WS_LIST, "ws map (moe)");
static_assert(WS_WIN + (size_t)ZC * D * 2 <= WS_WBR && WS_WUP + (size_t)NEX * 1024 * D * 2 <= WS_WDN && WS_WDN + (size_t)D * HK * 2 <= WS_XB, "ws map (weights)");
static_assert(WS_Z + (size_t)T * ZC * 2 <= WS_GQ, "ws map (acts)");
constexpr int CW_BAR = 4096, CW_CNT = 16384;
constexpr int TAB_OFF = 131072 + 1024;
constexpr int LDS_BYTES = 163840, MISC_OFF = 131072 + 320;

__device__ __forceinline__ float bflo(unsigned w) { return __uint_as_float(w << 16); }
__device__ __forceinline__ float bfhi(unsigned w) { return __uint_as_float(w & 0xffff0000u); }
__device__ __forceinline__ unsigned f2bf(float f) { unsigned u = __float_as_uint(f); return (u + 0x7fffu + ((u >> 16) & 1u)) >> 16; }
__device__ __forceinline__ unsigned pk2(float lo, float hi) { return f2bf(lo) | (f2bf(hi) << 16); }
template <int CTRL> __device__ __forceinline__ float dpp(float x) { return __builtin_bit_cast(float, __builtin_amdgcn_mov_dpp(__builtin_bit_cast(int, x), CTRL, 0xf, 0xf, true)); }
__device__ __forceinline__ float sum4(float x) { x += dpp<0xB1>(x); x += dpp<0x4E>(x); return x; }
__device__ __forceinline__ float sum8(float x) { x = sum4(x); x += dpp<0x141>(x); return x; }
__device__ __forceinline__ float sum16(float x) { x = sum8(x); x += dpp<0x140>(x); return x; }
__device__ __forceinline__ float wave_sum(float x) { x = sum16(x); x += __shfl_xor(x, 16); x += __shfl_xor(x, 32); return x; }
__device__ __forceinline__ float max8(float x) { x = fmaxf(x, dpp<0xB1>(x)); x = fmaxf(x, dpp<0x4E>(x)); x = fmaxf(x, dpp<0x141>(x)); return x; }
__device__ __forceinline__ float min8(float x) { x = fminf(x, dpp<0xB1>(x)); x = fminf(x, dpp<0x4E>(x)); x = fminf(x, dpp<0x141>(x)); return x; }
__device__ __forceinline__ float wave_scan_incl(float v) {
    v += __builtin_bit_cast(float, __builtin_amdgcn_update_dpp(0, __builtin_bit_cast(int, v), 0x111, 0xf, 0xf, true));
    v += __builtin_bit_cast(float, __builtin_amdgcn_update_dpp(0, __builtin_bit_cast(int, v), 0x112, 0xf, 0xf, true));
    v += __builtin_bit_cast(float, __builtin_amdgcn_update_dpp(0, __builtin_bit_cast(int, v), 0x114, 0xf, 0xf, true));
    v += __builtin_bit_cast(float, __builtin_amdgcn_update_dpp(0, __builtin_bit_cast(int, v), 0x118, 0xf, 0xf, true));
    v += __builtin_bit_cast(float, __builtin_amdgcn_update_dpp(0, __builtin_bit_cast(int, v), 0x142, 0xa, 0xf, false));
    v += __builtin_bit_cast(float, __builtin_amdgcn_update_dpp(0, __builtin_bit_cast(int, v), 0x143, 0xc, 0xf, false));
    return v;
}
__device__ __forceinline__ float sigmoidf_(float x) { return 1.f / (1.f + __expf(-x)); }
__device__ __forceinline__ float siluf_(float x) { return x / (1.f + __expf(-x)); }
__device__ __forceinline__ float softplusf_(float x) { return fmaxf(x, 0.f) + __logf(1.f + __expf(-fabsf(x))); }
__device__ __forceinline__ float gelu_tanh(float x) { const float y = 0.7978845608f * (x + 0.044715f * x * x * x); const float t = 1.f - 2.f / (__expf(2.f * y) + 1.f); return 0.5f * x * (1.f + t); }
__device__ __forceinline__ void unpack8(const v4u r, float (&f)[8]) { f[0] = bflo(r.x); f[1] = bfhi(r.x); f[2] = bflo(r.y); f[3] = bfhi(r.y); f[4] = bflo(r.z); f[5] = bfhi(r.z); f[6] = bflo(r.w); f[7] = bfhi(r.w); }
#define XB_TMO      128
#define XB_XCNT(j)  (256  + 64 * (j))
#define XB_XSUB(j)  (1280 + 64 * (j))
#define XB_XGEN(j)  (2304 + 64 * (j))
#define XB_TOP      3328
#define XB_TOPGEN   3392
#define XCD_BAR_WORDS 3456
#define XB_SPIN_CAP (1u << 18)

__device__ __forceinline__ unsigned xb_ld(unsigned* p)              { return __hip_atomic_load(p, __ATOMIC_RELAXED, __HIP_MEMORY_SCOPE_AGENT); }
__device__ __forceinline__ unsigned xb_add(unsigned* p, unsigned v) { return __hip_atomic_fetch_add(p, v, __ATOMIC_RELAXED, __HIP_MEMORY_SCOPE_AGENT); }
__device__ __forceinline__ unsigned xb_xcc_id() { return (unsigned)__builtin_amdgcn_s_getreg((3 << 11) | 20) & 0xFu; }
#define XB_SPIN(cond, bar) do { unsigned _sp = 0; while (cond) { __builtin_amdgcn_s_sleep(1); \
    if ((++_sp & 255u) == 0u) { if (xb_ld(&(bar)[XB_TMO])) break; if (_sp > XB_SPIN_CAP) { atomicAdd(&(bar)[XB_TMO], 1u); break; } } } } while (0)

struct XcdBarrier {
    unsigned* bar; unsigned x;
    volatile LAS unsigned* st;
};

__device__ __forceinline__ XcdBarrier xcd_barrier_post(unsigned* bar, volatile LAS unsigned* st) {
    XcdBarrier b; b.bar = bar; b.x = xb_xcc_id(); b.st = st;
    if (threadIdx.x == 0) (void)xb_add(&bar[XB_XCNT(b.x)], 1u);
    return b;
}
__device__ __forceinline__ void xcd_barrier_complete(unsigned* bar, unsigned x, unsigned& nloc, unsigned& nx) {
    const unsigned G = gridDim.x * gridDim.y * gridDim.z;
    unsigned sum, cnt, mine, sp = 0u;
    for (;;) {
        sum = 0u; cnt = 0u; mine = 0u;
#pragma unroll
        for (unsigned j = 0; j < 16; ++j) { const unsigned c = xb_ld(&bar[XB_XCNT(j)]); sum += c; cnt += (c > 0u) ? 1u : 0u; mine = (j == x) ? c : mine; }
        if (sum == G) break;
        __builtin_amdgcn_s_sleep(1);
        if ((++sp & 255u) == 0u) { if (xb_ld(&bar[XB_TMO])) break; if (sp > XB_SPIN_CAP) { atomicAdd(&bar[XB_TMO], 1u); break; } }
    }
    nloc = mine > 0u ? mine : 1u; nx = cnt > 0u ? cnt : 1u;
}

__device__ __forceinline__ void xcd_barrier(const XcdBarrier& b) {
    asm volatile("s_waitcnt vmcnt(0)" ::: "memory");
    __syncthreads();
    if (threadIdx.x == 0) {
        unsigned* bar = b.bar;
        __builtin_amdgcn_s_waitcnt(0);
        unsigned nloc = b.st[0], nx = b.st[1];
        if (nloc == 0u) { xcd_barrier_complete(bar, b.x, nloc, nx); b.st[0] = nloc; b.st[1] = nx; }
        const unsigned old = xb_add(&bar[XB_XSUB(b.x)], 1u);
        const unsigned gen = old / nloc;
        if (old + 1u == (gen + 1u) * nloc) {
            __builtin_amdgcn_fence(__ATOMIC_RELEASE, "agent");
            asm volatile("s_waitcnt vmcnt(0)" ::: "memory");
            const unsigned og = xb_add(&bar[XB_TOP], 1u);
            const unsigned tg = og / nx;
            if (og + 1u == (tg + 1u) * nx) xb_add(&bar[XB_TOPGEN], 1u);
            else XB_SPIN(xb_ld(&bar[XB_TOPGEN]) == tg, bar);
            __builtin_amdgcn_fence(__ATOMIC_ACQUIRE, "agent");
            xb_add(&bar[XB_XGEN(b.x)], 1u);
            asm volatile("s_waitcnt vmcnt(0)" ::: "memory");
        } else {
            XB_SPIN(xb_ld(&bar[XB_XGEN(b.x)]) == gen, bar);
            __builtin_amdgcn_fence(__ATOMIC_ACQUIRE, "agent");
            asm volatile("s_waitcnt vmcnt(0)" ::: "memory");
        }
    }
    __syncthreads();
}

struct Params { const float* in[27]; float* out; unsigned char* ws; int ph_lo, ph_hi; };
enum { I_X = 0, I_WIN, I_GMNG, I_GMNB, I_GMWS, I_GMBS, I_CONVW, I_ALOG, I_DTB, I_GDNNG, I_MLIB, I_MLFB, I_MLNG, I_WBR, I_WOUT, I_LN1G, I_LN1B,
       I_WR, I_RB, I_WG, I_WU, I_WD, I_SG, I_SU, I_SD, I_LN2G, I_LN2B };

using pg8::f32x4; using pg8::u32x4; using pg8::Unit; using pg8::HALF; using pg8::BM;

struct EpiMergeH {
    static constexpr bool PERM = true, AFTER_DRAIN = false; static constexpr int MID = BW / pg8::BK;
    const bf16* Z; bf16* msum;
    __device__ __forceinline__ void mid(f32x4 (&acc)[2][2][4][2], const Unit& u, int j, int wr, int wc, int fr, int fq) const {
        int row0 = u.pm * BM + wr * 64 + fr; const int col0 = u.pn * BM + wc * 32 + 8 * fq; asm volatile("" : "+v"(row0));
        const bf16* zp = Z + ZC_GATE + (size_t)(j - 1) * D + col0;
#pragma unroll
        for (int am = 0; am < 4; ++am) { const int ai = am >> 1, m0 = (am & 1) * 2; v4u ga[2][2], gb[2][2];
#pragma unroll
            for (int m = 0; m < 2; ++m)
#pragma unroll
                for (int bj = 0; bj < 2; ++bj) { const bf16* q = zp + (size_t)(row0 + ai * HALF + (m0 + m) * 16) * ZC + bj * HALF; ga[m][bj] = *(const v4u*)q; gb[m][bj] = *(const v4u*)(q + D); }
#pragma unroll
            for (int m = 0; m < 2; ++m)
#pragma unroll
                for (int bj = 0; bj < 2; ++bj) { float a[8], b[8]; unpack8(ga[m][bj], a); unpack8(gb[m][bj], b);
#pragma unroll
                    for (int i = 0; i < 8; ++i) { const float ea = __builtin_amdgcn_exp2f(fmaxf(a[i], -60.f) * -1.44269504f), eb = __builtin_amdgcn_exp2f(fmaxf(b[i], -60.f) * -1.44269504f);
                        acc[ai][bj][m0 + m][i >> 2][i & 3] *= (1.f + eb) * __builtin_amdgcn_rcpf(1.f + ea); } }
            asm volatile("" ::: "memory"); }
    }
    __device__ __forceinline__ void operator()(const f32x4 (&acc)[2][2][4][2], const Unit& u, int wr, int wc, int fr, int fq) const {
        const int row0 = u.pm * BM + wr * 64 + fr, col0 = u.pn * BM + wc * 32 + 8 * fq;
#pragma unroll
        for (int ai = 0; ai < 2; ++ai) { v4u gg[4][2];
#pragma unroll
            for (int m = 0; m < 4; ++m)
#pragma unroll
                for (int bj = 0; bj < 2; ++bj) gg[m][bj] = *(const v4u*)(Z + (size_t)(row0 + ai * HALF + m * 16) * ZC + ZC_GATE + 3 * D + col0 + bj * HALF);
#pragma unroll
            for (int m = 0; m < 4; ++m)
#pragma unroll
                for (int bj = 0; bj < 2; ++bj) { const size_t row = (size_t)(row0 + ai * HALF + m * 16); const int col = col0 + bj * HALF; float gl[8]; unpack8(gg[m][bj], gl);
                    f32x4 v0 = acc[ai][bj][m][0], v1 = acc[ai][bj][m][1];
#pragma unroll
                    for (int j = 0; j < 4; ++j) { v0[j] *= sigmoidf_(gl[j]); v1[j] *= sigmoidf_(gl[4 + j]); }
                    unsigned w0 = 0, w1 = 0; w0 = __builtin_amdgcn_cvt_pk_fp8_f32(v0[0], v0[1], w0, false); w0 = __builtin_amdgcn_cvt_pk_fp8_f32(v0[2], v0[3], w0, true); w1 = __builtin_amdgcn_cvt_pk_fp8_f32(v1[0], v1[1], w1, false); w1 = __builtin_amdgcn_cvt_pk_fp8_f32(v1[2], v1[3], w1, true);
                    *(v2u*)((unsigned char*)msum + row * D + col) = (v2u){w0, w1}; }
            asm volatile("" ::: "memory"); }
    }
};
struct EpiResid {
    static constexpr bool PERM = false, AFTER_DRAIN = false; static constexpr int MID = 0;
    const float* X; float* Y; float sc;
    __device__ __forceinline__ void operator()(const f32x4 (&acc)[2][2][4][2], const Unit& u, int wr, int wc, int fr, int fq) const {
        const int row0 = u.pm * BM + wr * 64 + fr, col0 = u.pn * BM + wc * 32 + 4 * fq;
#pragma unroll
        for (int ai = 0; ai < 2; ++ai)
#pragma unroll
            for (int m = 0; m < 4; ++m) { const size_t off = (size_t)(row0 + ai * HALF + m * 16) * D + col0;
#pragma unroll
                for (int bj = 0; bj < 2; ++bj)
#pragma unroll
                    for (int n = 0; n < 2; ++n) { const f32x4 xv = *(const f32x4*)(X + off + bj * HALF + n * 16); *(f32x4*)(Y + off + bj * HALF + n * 16) = xv * ALPHA + acc[ai][bj][m][n] * sc; } }
    }
};
struct MoeTab {
    LAS int* t; LAS unsigned short* tok; LAS float* wt; LAS unsigned char* mte;
    __device__ __forceinline__ MoeTab(LAS unsigned char* lds) : t((LAS int*)(lds + TAB_OFF)), tok((LAS unsigned short*)(lds + TAB_OFF + 1024)), wt((LAS float*)(lds + TAB_OFF + 5120)), mte((LAS unsigned char*)(lds + TAB_OFF + 13312)) {}
};
__device__ __forceinline__ void moe_tables(const MoeTab& M, const unsigned* cnt  , int tid, int lane, int wave) {
    __syncthreads();
    if (wave == 0) { const int c = (int)cnt[64 * lane]; const int tiles = (c + 255) >> 8; const float incl = wave_scan_incl((float)tiles);
        M.t[80 + lane] = c; M.t[lane] = (int)incl - tiles; if (lane == 63) { M.t[64] = (int)incl; M.t[65] = (int)incl + T / 256; M.t[80 + 64] = T; } }
    __syncthreads();
    const int Mt = M.t[65];
    for (int mt = tid; mt < Mt; mt += 512) { int e = 0;
        for (int k = 1; k <= 64; ++k) e = (M.t[k] <= mt) ? k : e;
        M.mte[mt] = (unsigned char)e; }
    __syncthreads();
}
struct UpOrder {
    MoeTab M; int n;
    __device__ __forceinline__ bool next(int i, Unit& u) const { if (i >= n) return false; u.pm = M.t[168 + i]; u.pn = M.t[176 + i]; u.aux = i; return true; }
    __device__ __forceinline__ int row_token(int i, int r) const { return (int)M.tok[i * 256 + r]; }
    __device__ __forceinline__ void a_ready(const Unit&) const {}
    __device__ __forceinline__ void done(const Unit&) const {}
};
__device__ __forceinline__ int up_order_build(const MoeTab& M, const int* LIST, const float* WL, int wg, int G, int tid) {
    const int U = 4 * M.t[65];
    if (tid < 8) { const int L = tid * G + wg; if (L < U) { const int mt = L >> 2, q = L & 3, e = M.mte[mt]; M.t[168 + tid] = mt; M.t[176 + tid] = e * 4 + q; M.t[184 + tid] = e; M.t[192 + tid] = mt - M.t[e]; } }
    int n = 0;
#pragma unroll
    for (int i = 0; i < 8; ++i) n += (i * G + wg < U) ? 1 : 0;
    __syncthreads();
    for (int idx = tid; idx < n * 256; idx += 512) { const int i = idx >> 8, r = idx & 255, e = M.t[184 + i], li = M.t[192 + i] * 256 + r;
        int tk = 0; float w = 0.f;
        if (e < NE) { if (li < M.t[80 + e]) { tk = LIST[e * T + li]; w = WL[e * T + li]; } } else { tk = li; w = 1.f; }
        M.tok[idx] = (unsigned short)tk; M.wt[idx] = w; }
    __syncthreads();
    return n;
}
struct EpiGluSparse {
    static constexpr bool PERM = true, AFTER_DRAIN = false; static constexpr int MID = 0;
    LAS const float* wt; bf16* H;
    __device__ __forceinline__ void operator()(const f32x4 (&acc)[2][2][4][2], const Unit& u, int wr, int wc, int fr, int fq) const {
        const int q = u.pn & 3; const int rl0 = wr * 64 + fr, col0 = q * 128 + wc * 32 + 8 * fq;
#pragma unroll
        for (int ai = 0; ai < 2; ++ai)
#pragma unroll
            for (int m = 0; m < 4; ++m) { const int rl = rl0 + ai * HALF + m * 16; const float c = wt[u.aux * 256 + rl]; float h[8];
#pragma unroll
                for (int n = 0; n < 2; ++n)
#pragma unroll
                    for (int j = 0; j < 4; ++j) h[4 * n + j] = siluf_(acc[ai][0][m][n][j] * UPSC) * (acc[ai][1][m][n][j] * UPSC) * c;
#if MOE_DN_FP8
#pragma unroll
                for (int j = 0; j < 8; ++j) h[j] = __builtin_amdgcn_fmed3f(h[j] * HSC, -448.f, 448.f);
                unsigned w0 = 0, w1 = 0; w0 = __builtin_amdgcn_cvt_pk_fp8_f32(h[0], h[1], w0, false); w0 = __builtin_amdgcn_cvt_pk_fp8_f32(h[2], h[3], w0, true); w1 = __builtin_amdgcn_cvt_pk_fp8_f32(h[4], h[5], w1, false); w1 = __builtin_amdgcn_cvt_pk_fp8_f32(h[6], h[7], w1, true);
                *(v2u*)((unsigned char*)H + ((size_t)u.pm * 256 + rl) * ED + col0) = (v2u){w0, w1}; }
#else
                u32x4 w; w.x = pk2(h[0], h[1]); w.y = pk2(h[2], h[3]); w.z = pk2(h[4], h[5]); w.w = pk2(h[6], h[7]);
                *(u32x4*)(H + ((size_t)u.pm * 256 + rl) * ED + col0) = w; }
#endif
    }
};
struct DownOrder {
    MoeTab M; int G, c, U;
    __device__ __forceinline__ bool next(int i, Unit& u) const { const int L = i * G + c; if (L >= U) return false; const int mt = L >> 3; u.pm = mt; u.pn = (int)M.mte[mt] * 8 + (L & 7); u.aux = 0; return true; }
    __device__ __forceinline__ void a_ready(const Unit&) const {}
    __device__ __forceinline__ void done(const Unit&) const {}
};
struct EpiYexp {
    static constexpr bool PERM = true, AFTER_DRAIN = false; static constexpr int MID = 0;
    bf16* Y;
    __device__ __forceinline__ void operator()(const f32x4 (&acc)[2][2][4][2], const Unit& u, int wr, int wc, int fr, int fq) const {
        const int row0 = u.pm * BM + wr * 64 + fr, col0 = (u.pn & 7) * BM + wc * 32 + 8 * fq;
#pragma unroll
        for (int ai = 0; ai < 2; ++ai)
#pragma unroll
            for (int m = 0; m < 4; ++m) { bf16* rowp = Y + (size_t)(row0 + ai * HALF + m * 16) * D + col0;
#pragma unroll
                for (int bj = 0; bj < 2; ++bj) { const f32x4 v0 = acc[ai][bj][m][0] * DNSC, v1 = acc[ai][bj][m][1] * DNSC;
                    u32x4 w; w.x = pk2(v0[0], v0[1]); w.y = pk2(v0[2], v0[3]); w.z = pk2(v1[0], v1[1]); w.w = pk2(v1[2], v1[3]); *(u32x4*)(rowp + bj * HALF) = w; } }
    }
};

struct TrItem { const float* src; bf16* dst; unsigned sld, dld; int f8; };
__device__ __forceinline__ void tr_load(const TrItem& t, int lane, v4f (&v)[8]) { const int r8 = lane >> 3, c4 = lane & 7;
#pragma unroll
    for (int i = 0; i < 8; ++i) v[i] = *(const v4f*)(t.src + (size_t)(8 * i + r8) * t.sld + 4 * c4); }
__device__ __forceinline__ void tr_store(const TrItem& t, const v4f (&v)[8], LAS float* scr, int lane, bool nostore = false) {
    { const int r8 = lane >> 3, c4 = lane & 7;
#pragma unroll
      for (int i = 0; i < 8; ++i) { LAS float* d = scr + (8 * i + r8) * 33 + 4 * c4; d[0] = v[i].x; d[1] = v[i].y; d[2] = v[i].z; d[3] = v[i].w; } }
    LDS_WAIT(); asm volatile("" ::: "memory");
    if (nostore) return;
    if (t.f8) {
        const int c = lane & 3;
#pragma unroll
        for (int j = 0; j < 2; ++j) { const int n = (lane >> 2) + 16 * j; const LAS float* s = scr + (16 * c) * 33 + n; unsigned w[4];
#pragma unroll
            for (int q = 0; q < 4; ++q) { unsigned x = 0; x = __builtin_amdgcn_cvt_pk_fp8_f32(s[(4 * q) * 33] * 64.f, s[(4 * q + 1) * 33] * 64.f, x, false); x = __builtin_amdgcn_cvt_pk_fp8_f32(s[(4 * q + 2) * 33] * 64.f, s[(4 * q + 3) * 33] * 64.f, x, true); w[q] = x; }
            *(v4u*)((unsigned char*)t.dst + (size_t)n * t.dld + 16 * c) = (v4u){w[0], w[1], w[2], w[3]}; }
    } else {
        const int c = lane & 7;
#pragma unroll
        for (int j = 0; j < 4; ++j) { const int n = (lane >> 3) + 8 * j; const LAS float* s = scr + (8 * c) * 33 + n;
            v4u o; o.x = pk2(s[0 * 33], s[1 * 33]); o.y = pk2(s[2 * 33], s[3 * 33]); o.z = pk2(s[4 * 33], s[5 * 33]); o.w = pk2(s[6 * 33], s[7 * 33]);
            *(v4u*)(t.dst + (size_t)n * t.dld + 8 * c) = o; }
    }
    LDS_WAIT(); asm volatile("" ::: "memory");
}
template <int PART> __device__ __forceinline__ TrItem tr_decode(const Params& p, int l, int it) {
    unsigned char* ws = p.ws;
    constexpr int N_IN = (ZC / 32) * (D / 64), N_BR = 4 * (BW / 64) * (D / 32), N_OUT = (D / 64) * (D / 32), N_UP = NEX * 2 * (D / 64) * (ED / 32);
    int r = it; TrItem t; t.f8 = 0;
    if (PART == 0) {
        const float* w_in = p.in[I_WIN] + (size_t)l * D * INC; const float* w_br = p.in[I_WBR] + (size_t)l * 4 * BW * D; const float* w_out = p.in[I_WOUT] + (size_t)l * D * D;
        bf16* WIN = (bf16*)(ws + WS_WIN); bf16* WBR = (bf16*)(ws + WS_WBR); bf16* WOUT = (bf16*)(ws + WS_WOUT);
        if (r < N_IN) { const int kb = r / (ZC / 32), n0 = (r % (ZC / 32)) * 32, k0 = kb * 64; const int sc = n0 + (n0 >= ZC_GATE ? 16 : (n0 >= ZC_MLQ ? 8 : 0));
            t.src = w_in + (size_t)k0 * INC + sc; t.sld = INC; t.dst = (bf16*)((unsigned char*)WIN + (size_t)n0 * D + k0); t.dld = D; t.f8 = 1; return t; } r -= N_IN;
        if (r < N_BR) { const int g = r / 512, rr = r % 512, k0 = (rr / 64) * 64, n0 = (rr % 64) * 32;
            t.src = w_br + ((size_t)g * BW + k0) * D + n0; t.sld = D; t.dst = WBR + (size_t)n0 * BRW + g * BW + k0; t.dld = BRW; return t; } r -= N_BR;
        { const int k0 = (r / 64) * 64, n0 = (r % 64) * 32; t.src = w_out + (size_t)k0 * D + n0; t.sld = D; t.dst = (bf16*)((unsigned char*)WOUT + (size_t)n0 * D + k0); t.dld = D; t.f8 = 1; return t; }
    } else {
        const float* w_g = p.in[I_WG] + (size_t)l * NE * D * ED; const float* w_u = p.in[I_WU] + (size_t)l * NE * D * ED; const float* w_d = p.in[I_WD] + (size_t)l * NE * ED * D;
        const float* s_g = p.in[I_SG] + (size_t)l * D * ED; const float* s_u = p.in[I_SU] + (size_t)l * D * ED; const float* s_d = p.in[I_SD] + (size_t)l * ED * D;
        bf16* WUP = (bf16*)(ws + WS_WUP); bf16* WDN = (bf16*)(ws + WS_WDN);
        if (r < N_UP) { const int e = r / 1024, rr = r % 1024, mat = rr / 512, r2 = rr % 512, k0 = (r2 / 16) * 64, n0 = (r2 % 16) * 32;
            const float* sb = (e < NE) ? ((mat ? w_u : w_g) + (size_t)e * D * ED) : (mat ? s_u : s_g);
            const int drow = e * 1024 + (n0 / 128) * 256 + mat * 128 + (n0 % 128);
            t.src = sb + (size_t)k0 * ED + n0; t.sld = ED;
#if MOE_UP_FP8
            t.dst = (bf16*)((unsigned char*)WUP + (size_t)drow * D + k0); t.dld = D; t.f8 = 1; return t; }
#else
            t.dst = WUP + (size_t)drow * D + k0; t.dld = D; return t; }
#endif
        r -= N_UP;
        { const int e = r / 512, rr = r % 512, k0 = (rr / 64) * 64, n0 = (rr % 64) * 32;
            const float* sb = (e < NE) ? (w_d + (size_t)e * ED * D) : s_d;
            t.src = sb + (size_t)k0 * D + n0; t.sld = D;
#if MOE_DN_FP8
            t.dst = (bf16*)((unsigned char*)WDN + ((size_t)e * D + n0) * ED + k0); t.dld = ED; t.f8 = 1; return t; }
#else
            t.dst = WDN + ((size_t)e * D + n0) * ED + k0; t.dld = ED; return t; }
#endif
    }
}
template <int PART> __device__ __forceinline__ void phase_convert(const Params& p, int l, LAS unsigned char* lds, int gw, int NGW, int wave, int lane, bool nostore = false) {
    constexpr int N_IN = (ZC / 32) * (D / 64), N_BR = 4 * (BW / 64) * (D / 32), N_OUT = (D / 64) * (D / 32), N_UP = NEX * 2 * (D / 64) * (ED / 32), N_DN = NEX * (ED / 64) * (D / 32);
    constexpr int NITEMS = (PART == 0) ? (N_IN + N_BR + N_OUT) : (N_UP + N_DN);
    LAS float* scr = (LAS float*)(lds + wave * 16384);
    if (gw >= NITEMS) return;
    TrItem cur = tr_decode<PART>(p, l, gw); v4f va[8], vb[8];
    tr_load(cur, lane, va);
    for (int it = gw; it < NITEMS; it += 2 * NGW) {
        const int i1 = it + NGW, i2 = it + 2 * NGW; TrItem nx = cur;
        if (i1 < NITEMS) { nx = tr_decode<PART>(p, l, i1); } tr_load(nx, lane, vb);
        tr_store(cur, va, scr, lane, nostore);
        if (i1 >= NITEMS) break;
        cur = nx; if (i2 < NITEMS) { cur = tr_decode<PART>(p, l, i2); } tr_load(cur, lane, va);
        tr_store(nx, vb, scr, lane, nostore);
        if (i2 >= NITEMS) break;
    }
}
__device__ __forceinline__ void phase_xprep(const Params& p, int l, const float* xin, LAS unsigned char* lds, int gw, int NGW, int tid, int lane) {
    const float* w_in = p.in[I_WIN] + (size_t)l * D * INC;
    constexpr int XP = 2052; LAS float* xt = (LAS float*)lds; LAS float* part = (LAS float*)lds;
    const int wave = tid >> 6, n_l = lane & 15, kq = lane >> 4, wg = gw >> 3, G = NGW >> 3;
    const int colw = n_l < 8 ? 4608 + n_l : 6152 + (n_l - 8);
    float bw[64];
#pragma unroll
    for (int q = 0; q < 64; ++q) bw[q] = w_in[(size_t)(256 * wave + 16 * (q >> 2) + 4 * kq + (q & 3)) * INC + colw];
    unsigned char* XB = p.ws + WS_XB; float* SMALL = (float*)(p.ws + WS_SMALL);
    __syncthreads();
    for (int tg = wg; tg < T / 16; tg += G) {
        {   v4f va[8], vb[8]; const size_t m0 = (size_t)tg * 16 + 2 * wave;
            const v4f* xa = (const v4f*)(xin + m0 * D) + lane; const v4f* xb = (const v4f*)(xin + (m0 + 1) * D) + lane;
#pragma unroll
            for (int j = 0; j < 8; ++j) { va[j] = xa[64 * j]; vb[j] = xb[64 * j]; }
#pragma unroll
            for (int rr = 0; rr < 2; ++rr) { unsigned* xo = (unsigned*)(XB + (m0 + rr) * D) + lane;
#pragma unroll
                for (int j = 0; j < 8; ++j) { const v4f v = rr ? vb[j] : va[j]; unsigned w = 0; w = __builtin_amdgcn_cvt_pk_fp8_f32(v.x, v.y, w, false); w = __builtin_amdgcn_cvt_pk_fp8_f32(v.z, v.w, w, true); xo[64 * j] = w;
                    *(LAS v4f*)(xt + (2 * wave + rr) * XP + 4 * lane + 256 * j) = v; } } }
        __syncthreads();
        {   pg8::f32x4 acc[4];
#pragma unroll
            for (int i = 0; i < 4; ++i) acc[i] = (pg8::f32x4){0.f, 0.f, 0.f, 0.f};
            const LAS float* xa = xt + n_l * XP + 256 * wave + 4 * kq;
#pragma unroll
            for (int s2 = 0; s2 < 16; ++s2) { const v4f a4 = *(const LAS v4f*)(xa + 16 * s2);
                acc[0] = __builtin_amdgcn_mfma_f32_16x16x4f32(a4.x, bw[4 * s2 + 0], acc[0], 0, 0, 0); acc[1] = __builtin_amdgcn_mfma_f32_16x16x4f32(a4.y, bw[4 * s2 + 1], acc[1], 0, 0, 0);
                acc[2] = __builtin_amdgcn_mfma_f32_16x16x4f32(a4.z, bw[4 * s2 + 2], acc[2], 0, 0, 0); acc[3] = __builtin_amdgcn_mfma_f32_16x16x4f32(a4.w, bw[4 * s2 + 3], acc[3], 0, 0, 0); }
            const pg8::f32x4 tot = (acc[0] + acc[1]) + (acc[2] + acc[3]);
            __syncthreads();
#pragma unroll
            for (int j = 0; j < 4; ++j) part[(wave * 16 + 4 * kq + j) * 16 + n_l] = tot[j]; }
        __syncthreads();
        if (tid < 256) { float a = 0.f;
#pragma unroll
            for (int w = 0; w < 8; ++w) a += part[w * 256 + tid];
            SMALL[(size_t)tg * 256 + tid] = a; }
        __syncthreads();
    }
}


typedef short bf16x8_t __attribute__((ext_vector_type(8)));
__device__ __forceinline__ void ml_pre_item(const Params& p, int l, LAS unsigned char* lds, int item, int tid, int wave, int lane) {
    const int h = item & 3, n = item >> 2; const size_t t0 = (size_t)n * 64;
    const bf16* Z = (const bf16*)(p.ws + WS_Z); const float* SMALL = (const float*)(p.ws + WS_SMALL);
    bf16* MQ = (bf16*)(p.ws + WS_MQ) + (size_t)item * 4096; bf16* MS = (bf16*)(p.ws + WS_MS) + (size_t)item * 4096; bf16* MK = (bf16*)(p.ws + WS_MK) + (size_t)item * 4096;
    bf16* MV = (bf16*)(p.ws + WS_MV) + (size_t)item * 9216; float* MFL = (float*)(p.ws + WS_MFL);
    LAS float* qs = (LAS float*)lds;
    LAS float* ks = qs + 64 * 65;
    LAS float* bs = ks + 64 * 65;
    LAS unsigned short* vs = (LAS unsigned short*)(bs + 128);
    { const int tk = tid >> 3, c8 = tid & 7; float f[8];
      unpack8(*(const v4u*)(Z + (t0 + tk) * ZC + ZC_MLQ + h * 64 + 8 * c8), f);
#pragma unroll
      for (int i = 0; i < 8; ++i) qs[tk * 65 + 8 * c8 + i] = f[i];
      unpack8(*(const v4u*)(Z + (t0 + tk) * ZC + ZC_MLK + h * 64 + 8 * c8), f);
#pragma unroll
      for (int i = 0; i < 8; ++i) ks[tk * 65 + 8 * c8 + i] = f[i]; }
#pragma unroll
    for (int r = 0; r < 2; ++r) { const int idx = tid + 512 * r, tk = idx >> 4, c8 = idx & 15;
        *(LAS v4u*)(vs + tk * 136 + 8 * c8) = *(const v4u*)(Z + (t0 + tk) * ZC + ZC_MLV + h * 128 + 8 * c8); }
    if (wave == 0) { const float fp = SMALL[(t0 + lane) * 16 + 12 + h] + p.in[I_MLFB][l * 4 + h]; const float lf = -softplusf_(-fp);
        bs[lane] = wave_scan_incl(lf); bs[64 + lane] = SMALL[(t0 + lane) * 16 + 8 + h] + p.in[I_MLIB][l * 4 + h]; }
    __syncthreads();
    const float blast = bs[63];
    { const int i = tid >> 3, jb = tid & 7; const float bi = bs[i];
      { const float e = __expf(bi) * 0.125f; float o[8];
#pragma unroll
        for (int x = 0; x < 8; ++x) o[x] = qs[i * 65 + 8 * jb + x] * e;
        v4u w; w.x = pk2(o[0], o[1]); w.y = pk2(o[2], o[3]); w.z = pk2(o[4], o[5]); w.w = pk2(o[6], o[7]); *(v4u*)(MQ + i * 64 + 8 * jb) = w; }
      { float d[8];
#pragma unroll
        for (int x = 0; x < 8; ++x) d[x] = 0.f;
        if (8 * jb <= i) {
            for (int dd = 0; dd < 64; ++dd) { const float qv = qs[i * 65 + dd];
#pragma unroll
                for (int x = 0; x < 8; ++x) d[x] += qv * ks[(8 * jb + x) * 65 + dd]; }
#pragma unroll
            for (int x = 0; x < 8; ++x) { const int j = 8 * jb + x; d[x] = (j <= i) ? __expf(bi - bs[j] + bs[64 + j]) * d[x] * 0.125f : 0.f; } }
        v4u w; w.x = pk2(d[0], d[1]); w.y = pk2(d[2], d[3]); w.z = pk2(d[4], d[5]); w.w = pk2(d[6], d[7]); *(v4u*)(MS + i * 64 + 8 * jb) = w; }
      { float o[8];
#pragma unroll
        for (int x = 0; x < 8; ++x) { const int j = 8 * jb + x; o[x] = ks[j * 65 + i] * __expf(blast - bs[j] + bs[64 + j]); }
        v4u w; w.x = pk2(o[0], o[1]); w.y = pk2(o[2], o[3]); w.z = pk2(o[4], o[5]); w.w = pk2(o[6], o[7]); *(v4u*)(MK + i * 64 + 8 * jb) = w; }
    }
    { const int c = tid >> 2, jq = tid & 3; unsigned w[8];
#pragma unroll
      for (int x = 0; x < 8; ++x) w[x] = (unsigned)vs[(16 * jq + 2 * x) * 136 + c] | ((unsigned)vs[(16 * jq + 2 * x + 1) * 136 + c] << 16);
      *(v4u*)(MV + c * 64 + 16 * jq) = (v4u){w[0], w[1], w[2], w[3]}; *(v4u*)(MV + c * 64 + 16 * jq + 8) = (v4u){w[4], w[5], w[6], w[7]};
      if (tid < 64) { const int c2 = 128 + (tid >> 2); const unsigned one = (c2 == 128) ? 0x3F803F80u : 0u;
          *(v4u*)(MV + c2 * 64 + 16 * jq) = (v4u){one, one, one, one}; *(v4u*)(MV + c2 * 64 + 16 * jq + 8) = (v4u){one, one, one, one}; } }
    if (tid == 0) MFL[item] = __expf(blast);
    __syncthreads();
}
struct MlFrags { bf16x8_t q[2], s[2], kt[2], vt[2]; float fl; };
__device__ __forceinline__ void ml_load(MlFrags& F, const Params& p, int item, int offA, int offV) {
    const bf16* MQ = (const bf16*)(p.ws + WS_MQ) + (size_t)item * 4096; const bf16* MS = (const bf16*)(p.ws + WS_MS) + (size_t)item * 4096; const bf16* MK = (const bf16*)(p.ws + WS_MK) + (size_t)item * 4096;
    const bf16* MV = (const bf16*)(p.ws + WS_MV) + (size_t)item * 9216;
#pragma unroll
    for (int ks = 0; ks < 2; ++ks) { F.q[ks] = *(const bf16x8_t*)(MQ + offA + 32 * ks); F.s[ks] = *(const bf16x8_t*)(MS + offA + 32 * ks); F.kt[ks] = *(const bf16x8_t*)(MK + offA + 32 * ks); F.vt[ks] = *(const bf16x8_t*)(MV + offV + 32 * ks); }
    F.fl = ((const float*)(p.ws + WS_MFL))[item];
}
__device__ __forceinline__ void ml_seq(const Params& p, LAS unsigned char* lds, int wgi, int wave, int lane) {
    const int u = wgi * 2 + (wave >> 2), wi = wave & 3, h = u / 9, sl = u % 9, g = lane >> 4, c = lane & 15;
    LAS unsigned short* CT = (LAS unsigned short*)(lds + (wave >> 2) * 4096);
    float* HO = (float*)(p.ws + WS_HO); float* HDEN = (float*)(p.ws + WS_HDEN);
    const int offA = (16 * wi + c) * 64 + 8 * g, offV = (16 * sl + c) * 64 + 8 * g;
    *(LAS v2u*)(CT + c * 64 + 16 * wi + 4 * g) = (v2u){0u, 0u};
    pg8::f32x4 Cacc = {0.f, 0.f, 0.f, 0.f};
    __syncthreads();
    MlFrags F0, F1;
    ml_load(F0, p, h, offA, offV);
#define ML_STEP(F, n_) do { const int cur = (n_) & 1; \
        const bf16x8_t c0 = *(const LAS bf16x8_t*)(CT + cur * 1024 + c * 64 + 8 * g), c1 = *(const LAS bf16x8_t*)(CT + cur * 1024 + c * 64 + 32 + 8 * g); \
        pg8::f32x4 num = {0.f, 0.f, 0.f, 0.f}; \
        num = __builtin_amdgcn_mfma_f32_16x16x32_bf16(F.q[0], c0, num, 0, 0, 0); num = __builtin_amdgcn_mfma_f32_16x16x32_bf16(F.q[1], c1, num, 0, 0, 0); \
        num = __builtin_amdgcn_mfma_f32_16x16x32_bf16(F.s[0], F.vt[0], num, 0, 0, 0); num = __builtin_amdgcn_mfma_f32_16x16x32_bf16(F.s[1], F.vt[1], num, 0, 0, 0); \
        Cacc = Cacc * F.fl; \
        Cacc = __builtin_amdgcn_mfma_f32_16x16x32_bf16(F.kt[0], F.vt[0], Cacc, 0, 0, 0); Cacc = __builtin_amdgcn_mfma_f32_16x16x32_bf16(F.kt[1], F.vt[1], Cacc, 0, 0, 0); \
        { v2u w; w.x = pk2(Cacc[0], Cacc[1]); w.y = pk2(Cacc[2], Cacc[3]); *(LAS v2u*)(CT + (cur ^ 1) * 1024 + c * 64 + 16 * wi + 4 * g) = w; } \
        { const size_t tb = (size_t)(n_) * 64 + 16 * wi + 4 * g; \
          if (sl < 8) { _Pragma("unroll") for (int r = 0; r < 4; ++r) HO[(tb + r) * BW + h * 128 + 16 * sl + c] = num[r]; } \
          else if (c == 0) { _Pragma("unroll") for (int r = 0; r < 4; ++r) HDEN[(tb + r) * 4 + h] = num[r]; } } \
        LDS_BAR(); } while (0)
    for (int n = 0; n < T / 64; n += 2) {
        ml_load(F1, p, (n + 1) * 4 + h, offA, offV);
        ML_STEP(F0, n);
        ml_load(F0, p, ((n + 2 < T / 64) ? n + 2 : n) * 4 + h, offA, offV);
        ML_STEP(F1, n + 1);
    }
#undef ML_STEP
}


constexpr int QP = 132;
__device__ __forceinline__ void gdn_pre_item(const Params& p, int l, LAS unsigned char* lds, int item, int tid, int wave, int lane) {
    const int h = item & 3, n = item >> 2; const size_t t0 = (size_t)n * 64;
    const bf16* Z = (const bf16*)(p.ws + WS_Z); const float* SMALL = (const float*)(p.ws + WS_SMALL);
    float* GU = (float*)(p.ws + WS_GU) + (size_t)item * 8192; bf16* GNW = (bf16*)(p.ws + WS_GNW) + (size_t)item * 8192; bf16* GQG = (bf16*)(p.ws + WS_GQG) + (size_t)item * 8192;
    bf16* GAT = (bf16*)(p.ws + WS_GAT) + (size_t)item * 4096; bf16* GKT = (bf16*)(p.ws + WS_GKT) + (size_t)item * 8192; float* GDL = (float*)(p.ws + WS_GDL);
    const float* cw = p.in[I_CONVW] + (size_t)l * 4 * 1536;
    LAS float* qs = (LAS float*)lds; LAS float* ks = qs + 64 * QP; LAS float* vs = ks + 64 * QP; LAS float* Ls = vs + 64 * QP;   LAS float* gcs = Ls + 64 * 68; LAS float* bts = gcs + 64; LAS float* btg = bts + 64;
    { const int tk = tid >> 3, part = tid & 7;
#pragma unroll 1
      for (int i = 0; i < 3; ++i) { float a[16];
#pragma unroll
        for (int x = 0; x < 16; ++x) a[x] = 0.f;
#pragma unroll
        for (int j = 0; j < 4; ++j) { const long tt = (long)t0 + tk - 3 + j; if (tt >= 0) {
            const bf16* src = Z + (size_t)tt * ZC + ZC_GDN + i * 512 + h * 128 + 16 * part; float x0[8], x1[8]; unpack8(*(const v4u*)src, x0); unpack8(*(const v4u*)(src + 8), x1);
            const float* wp = cw + j * 1536 + i * 512 + h * 128 + 16 * part;
#pragma unroll
            for (int x = 0; x < 8; ++x) { a[x] += wp[x] * x0[x]; a[8 + x] += wp[8 + x] * x1[x]; } } }
        float ss = 0.f;
#pragma unroll
        for (int x = 0; x < 16; ++x) { a[x] = siluf_(a[x]); ss += a[x] * a[x]; }
        if (i < 2) { ss = sum8(ss); const float r = rsqrtf(ss + 1e-6f) * (i == 0 ? 0.08838834764831845f : 1.f);
#pragma unroll
            for (int x = 0; x < 16; ++x) a[x] *= r; }
        LAS float* dst = (i == 0 ? qs : (i == 1 ? ks : vs)) + tk * QP + 16 * part;
#pragma unroll
        for (int x4 = 0; x4 < 4; ++x4) *(LAS v4f*)(dst + 4 * x4) = (v4f){a[4 * x4], a[4 * x4 + 1], a[4 * x4 + 2], a[4 * x4 + 3]}; } }
    if (wave == 0) { const float bb = SMALL[(t0 + lane) * 16 + h], aa = SMALL[(t0 + lane) * 16 + 4 + h];
        const float g = -__expf(p.in[I_ALOG][l * 4 + h]) * softplusf_(aa + p.in[I_DTB][l * 4 + h]);
        const float gc = wave_scan_incl(g), bt = sigmoidf_(bb); gcs[lane] = gc; bts[lane] = bt; btg[lane] = bt * __expf(gc); }
    __syncthreads();
    { const int i = tid >> 3, jb = tid & 7; const float gi = gcs[i], bi = bts[i]; float dk[8], dq[8];
#pragma unroll
      for (int x = 0; x < 8; ++x) { dk[x] = 0.f; dq[x] = 0.f; }
      if (8 * jb <= i) {
#pragma unroll 2
          for (int d4 = 0; d4 < 32; ++d4) { const v4f qi = *(const LAS v4f*)(qs + i * QP + 4 * d4), ki = *(const LAS v4f*)(ks + i * QP + 4 * d4);
#pragma unroll
              for (int x = 0; x < 8; ++x) { const v4f kj = *(const LAS v4f*)(ks + (8 * jb + x) * QP + 4 * d4);
                  dk[x] += ki.x * kj.x + ki.y * kj.y + ki.z * kj.z + ki.w * kj.w; dq[x] += qi.x * kj.x + qi.y * kj.y + qi.z * kj.z + qi.w * kj.w; } }
#pragma unroll
          for (int x = 0; x < 8; ++x) { const int j = 8 * jb + x; const float dc = __expf(gi - gcs[j]); dk[x] = (j < i) ? bi * dk[x] * dc : 0.f; dq[x] = (j <= i) ? dq[x] * dc : 0.f; } }
      *(LAS v4f*)(Ls + i * 68 + 8 * jb) = (v4f){dk[0], dk[1], dk[2], dk[3]}; *(LAS v4f*)(Ls + i * 68 + 8 * jb + 4) = (v4f){dk[4], dk[5], dk[6], dk[7]};
      v4u w; w.x = pk2(dq[0], dq[1]); w.y = pk2(dq[2], dq[3]); w.z = pk2(dq[4], dq[5]); w.w = pk2(dq[6], dq[7]); *(v4u*)(GAT + i * 64 + 8 * jb) = w; }
    __syncthreads();
    if (tid < 256) {
        const int c = tid; int vz; asm volatile("v_mov_b32 %0, 0" : "=v"(vz));
        const LAS float* rp = (c < 128) ? (vs + c) : (ks + (c - 128)); const LAS float* mp = ((c < 128) ? bts : btg) + vz;
#define GDN_RHS(i) (rp[(i) * QP] * mp[(i)])
#define GDN_L4(i, j4) (*(const LAS v4f*)(Ls + (i) * 68 + 4 * (j4) + vz))
        float x0 = GDN_RHS(0); __builtin_amdgcn_sched_barrier(0);
        float x1 = GDN_RHS(1); { const v4f l = GDN_L4(1, 0); x1 -= l.x * x0; } __builtin_amdgcn_sched_barrier(0);
        float x2 = GDN_RHS(2); { const v4f l = GDN_L4(2, 0); x2 -= l.x * x0; x2 -= l.y * x1; } __builtin_amdgcn_sched_barrier(0);
        float x3 = GDN_RHS(3); { const v4f l = GDN_L4(3, 0); x3 -= l.x * x0; x3 -= l.y * x1; x3 -= l.z * x2; } __builtin_amdgcn_sched_barrier(0);
        float x4 = GDN_RHS(4); { const v4f l = GDN_L4(4, 0); x4 -= l.x * x0; x4 -= l.y * x1; x4 -= l.z * x2; x4 -= l.w * x3; } __builtin_amdgcn_sched_barrier(0);
        float x5 = GDN_RHS(5); { const v4f l = GDN_L4(5, 0); x5 -= l.x * x0; x5 -= l.y * x1; x5 -= l.z * x2; x5 -= l.w * x3; } { const v4f l = GDN_L4(5, 1); x5 -= l.x * x4; } __builtin_amdgcn_sched_barrier(0);
        float x6 = GDN_RHS(6); { const v4f l = GDN_L4(6, 0); x6 -= l.x * x0; x6 -= l.y * x1; x6 -= l.z * x2; x6 -= l.w * x3; } { const v4f l = GDN_L4(6, 1); x6 -= l.x * x4; x6 -= l.y * x5; } __builtin_amdgcn_sched_barrier(0);
        float x7 = GDN_RHS(7); { const v4f l = GDN_L4(7, 0); x7 -= l.x * x0; x7 -= l.y * x1; x7 -= l.z * x2; x7 -= l.w * x3; } { const v4f l = GDN_L4(7, 1); x7 -= l.x * x4; x7 -= l.y * x5; x7 -= l.z * x6; } __builtin_amdgcn_sched_barrier(0);
        float x8 = GDN_RHS(8); { const v4f l = GDN_L4(8, 0); x8 -= l.x * x0; x8 -= l.y * x1; x8 -= l.z * x2; x8 -= l.w * x3; } { const v4f l = GDN_L4(8, 1); x8 -= l.x * x4; x8 -= l.y * x5; x8 -= l.z * x6; x8 -= l.w * x7; } __builtin_amdgcn_sched_barrier(0);
        float x9 = GDN_RHS(9); { const v4f l = GDN_L4(9, 0); x9 -= l.x * x0; x9 -= l.y * x1; x9 -= l.z * x2; x9 -= l.w * x3; } { const v4f l = GDN_L4(9, 1); x9 -= l.x * x4; x9 -= l.y * x5; x9 -= l.z * x6; x9 -= l.w * x7; } { const v4f l = GDN_L4(9, 2); x9 -= l.x * x8; } __builtin_amdgcn_sched_barrier(0);
        float x10 = GDN_RHS(10); { const v4f l = GDN_L4(10, 0); x10 -= l.x * x0; x10 -= l.y * x1; x10 -= l.z * x2; x10 -= l.w * x3; } { const v4f l = GDN_L4(10, 1); x10 -= l.x * x4; x10 -= l.y * x5; x10 -= l.z * x6; x10 -= l.w * x7; } { const v4f l = GDN_L4(10, 2); x10 -= l.x * x8; x10 -= l.y * x9; } __builtin_amdgcn_sched_barrier(0);
        float x11 = GDN_RHS(11); { const v4f l = GDN_L4(11, 0); x11 -= l.x * x0; x11 -= l.y * x1; x11 -= l.z * x2; x11 -= l.w * x3; } { const v4f l = GDN_L4(11, 1); x11 -= l.x * x4; x11 -= l.y * x5; x11 -= l.z * x6; x11 -= l.w * x7; } { const v4f l = GDN_L4(11, 2); x11 -= l.x * x8; x11 -= l.y * x9; x11 -= l.z * x10; } __builtin_amdgcn_sched_barrier(0);
        float x12 = GDN_RHS(12); { const v4f l = GDN_L4(12, 0); x12 -= l.x * x0; x12 -= l.y * x1; x12 -= l.z * x2; x12 -= l.w * x3; } { const v4f l = GDN_L4(12, 1); x12 -= l.x * x4; x12 -= l.y * x5; x12 -= l.z * x6; x12 -= l.w * x7; } { const v4f l = GDN_L4(12, 2); x12 -= l.x * x8; x12 -= l.y * x9; x12 -= l.z * x10; x12 -= l.w * x11; } __builtin_amdgcn_sched_barrier(0);
        float x13 = GDN_RHS(13); { const v4f l = GDN_L4(13, 0); x13 -= l.x * x0; x13 -= l.y * x1; x13 -= l.z * x2; x13 -= l.w * x3; } { const v4f l = GDN_L4(13, 1); x13 -= l.x * x4; x13 -= l.y * x5; x13 -= l.z * x6; x13 -= l.w * x7; } { const v4f l = GDN_L4(13, 2); x13 -= l.x * x8; x13 -= l.y * x9; x13 -= l.z * x10; x13 -= l.w * x11; } { const v4f l = GDN_L4(13, 3); x13 -= l.x * x12; } __builtin_amdgcn_sched_barrier(0);
        float x14 = GDN_RHS(14); { const v4f l = GDN_L4(14, 0); x14 -= l.x * x0; x14 -= l.y * x1; x14 -= l.z * x2; x14 -= l.w * x3; } { const v4f l = GDN_L4(14, 1); x14 -= l.x * x4; x14 -= l.y * x5; x14 -= l.z * x6; x14 -= l.w * x7; } { const v4f l = GDN_L4(14, 2); x14 -= l.x * x8; x14 -= l.y * x9; x14 -= l.z * x10; x14 -= l.w * x11; } { const v4f l = GDN_L4(14, 3); x14 -= l.x * x12; x14 -= l.y * x13; } __builtin_amdgcn_sched_barrier(0);
        float x15 = GDN_RHS(15); { const v4f l = GDN_L4(15, 0); x15 -= l.x * x0; x15 -= l.y * x1; x15 -= l.z * x2; x15 -= l.w * x3; } { const v4f l = GDN_L4(15, 1); x15 -= l.x * x4; x15 -= l.y * x5; x15 -= l.z * x6; x15 -= l.w * x7; } { const v4f l = GDN_L4(15, 2); x15 -= l.x * x8; x15 -= l.y * x9; x15 -= l.z * x10; x15 -= l.w * x11; } { const v4f l = GDN_L4(15, 3); x15 -= l.x * x12; x15 -= l.y * x13; x15 -= l.z * x14; } __builtin_amdgcn_sched_barrier(0);
        float x16 = GDN_RHS(16); { const v4f l = GDN_L4(16, 0); x16 -= l.x * x0; x16 -= l.y * x1; x16 -= l.z * x2; x16 -= l.w * x3; } { const v4f l = GDN_L4(16, 1); x16 -= l.x * x4; x16 -= l.y * x5; x16 -= l.z * x6; x16 -= l.w * x7; } { const v4f l = GDN_L4(16, 2); x16 -= l.x * x8; x16 -= l.y * x9; x16 -= l.z * x10; x16 -= l.w * x11; } { const v4f l = GDN_L4(16, 3); x16 -= l.x * x12; x16 -= l.y * x13; x16 -= l.z * x14; x16 -= l.w * x15; } __builtin_amdgcn_sched_barrier(0);
        float x17 = GDN_RHS(17); { const v4f l = GDN_L4(17, 0); x17 -= l.x * x0; x17 -= l.y * x1; x17 -= l.z * x2; x17 -= l.w * x3; } { const v4f l = GDN_L4(17, 1); x17 -= l.x * x4; x17 -= l.y * x5; x17 -= l.z * x6; x17 -= l.w * x7; } { const v4f l = GDN_L4(17, 2); x17 -= l.x * x8; x17 -= l.y * x9; x17 -= l.z * x10; x17 -= l.w * x11; } { const v4f l = GDN_L4(17, 3); x17 -= l.x * x12; x17 -= l.y * x13; x17 -= l.z * x14; x17 -= l.w * x15; } { const v4f l = GDN_L4(17, 4); x17 -= l.x * x16; } __builtin_amdgcn_sched_barrier(0);
        float x18 = GDN_RHS(18); { const v4f l = GDN_L4(18, 0); x18 -= l.x * x0; x18 -= l.y * x1; x18 -= l.z * x2; x18 -= l.w * x3; } { const v4f l = GDN_L4(18, 1); x18 -= l.x * x4; x18 -= l.y * x5; x18 -= l.z * x6; x18 -= l.w * x7; } { const v4f l = GDN_L4(18, 2); x18 -= l.x * x8; x18 -= l.y * x9; x18 -= l.z * x10; x18 -= l.w * x11; } { const v4f l = GDN_L4(18, 3); x18 -= l.x * x12; x18 -= l.y * x13; x18 -= l.z * x14; x18 -= l.w * x15; } { const v4f l = GDN_L4(18, 4); x18 -= l.x * x16; x18 -= l.y * x17; } __builtin_amdgcn_sched_barrier(0);
        float x19 = GDN_RHS(19); { const v4f l = GDN_L4(19, 0); x19 -= l.x * x0; x19 -= l.y * x1; x19 -= l.z * x2; x19 -= l.w * x3; } { const v4f l = GDN_L4(19, 1); x19 -= l.x * x4; x19 -= l.y * x5; x19 -= l.z * x6; x19 -= l.w * x7; } { const v4f l = GDN_L4(19, 2); x19 -= l.x * x8; x19 -= l.y * x9; x19 -= l.z * x10; x19 -= l.w * x11; } { const v4f l = GDN_L4(19, 3); x19 -= l.x * x12; x19 -= l.y * x13; x19 -= l.z * x14; x19 -= l.w * x15; } { const v4f l = GDN_L4(19, 4); x19 -= l.x * x16; x19 -= l.y * x17; x19 -= l.z * x18; } __builtin_amdgcn_sched_barrier(0);
        float x20 = GDN_RHS(20); { const v4f l = GDN_L4(20, 0); x20 -= l.x * x0; x20 -= l.y * x1; x20 -= l.z * x2; x20 -= l.w * x3; } { const v4f l = GDN_L4(20, 1); x20 -= l.x * x4; x20 -= l.y * x5; x20 -= l.z * x6; x20 -= l.w * x7; } { const v4f l = GDN_L4(20, 2); x20 -= l.x * x8; x20 -= l.y * x9; x20 -= l.z * x10; x20 -= l.w * x11; } { const v4f l = GDN_L4(20, 3); x20 -= l.x * x12; x20 -= l.y * x13; x20 -= l.z * x14; x20 -= l.w * x15; } { const v4f l = GDN_L4(20, 4); x20 -= l.x * x16; x20 -= l.y * x17; x20 -= l.z * x18; x20 -= l.w * x19; } __builtin_amdgcn_sched_barrier(0);
        float x21 = GDN_RHS(21); { const v4f l = GDN_L4(21, 0); x21 -= l.x * x0; x21 -= l.y * x1; x21 -= l.z * x2; x21 -= l.w * x3; } { const v4f l = GDN_L4(21, 1); x21 -= l.x * x4; x21 -= l.y * x5; x21 -= l.z * x6; x21 -= l.w * x7; } { const v4f l = GDN_L4(21, 2); x21 -= l.x * x8; x21 -= l.y * x9; x21 -= l.z * x10; x21 -= l.w * x11; } { const v4f l = GDN_L4(21, 3); x21 -= l.x * x12; x21 -= l.y * x13; x21 -= l.z * x14; x21 -= l.w * x15; } { const v4f l = GDN_L4(21, 4); x21 -= l.x * x16; x21 -= l.y * x17; x21 -= l.z * x18; x21 -= l.w * x19; } { const v4f l = GDN_L4(21, 5); x21 -= l.x * x20; } __builtin_amdgcn_sched_barrier(0);
        float x22 = GDN_RHS(22); { const v4f l = GDN_L4(22, 0); x22 -= l.x * x0; x22 -= l.y * x1; x22 -= l.z * x2; x22 -= l.w * x3; } { const v4f l = GDN_L4(22, 1); x22 -= l.x * x4; x22 -= l.y * x5; x22 -= l.z * x6; x22 -= l.w * x7; } { const v4f l = GDN_L4(22, 2); x22 -= l.x * x8; x22 -= l.y * x9; x22 -= l.z * x10; x22 -= l.w * x11; } { const v4f l = GDN_L4(22, 3); x22 -= l.x * x12; x22 -= l.y * x13; x22 -= l.z * x14; x22 -= l.w * x15; } { const v4f l = GDN_L4(22, 4); x22 -= l.x * x16; x22 -= l.y * x17; x22 -= l.z * x18; x22 -= l.w * x19; } { const v4f l = GDN_L4(22, 5); x22 -= l.x * x20; x22 -= l.y * x21; } __builtin_amdgcn_sched_barrier(0);
        float x23 = GDN_RHS(23); { const v4f l = GDN_L4(23, 0); x23 -= l.x * x0; x23 -= l.y * x1; x23 -= l.z * x2; x23 -= l.w * x3; } { const v4f l = GDN_L4(23, 1); x23 -= l.x * x4; x23 -= l.y * x5; x23 -= l.z * x6; x23 -= l.w * x7; } { const v4f l = GDN_L4(23, 2); x23 -= l.x * x8; x23 -= l.y * x9; x23 -= l.z * x10; x23 -= l.w * x11; } { const v4f l = GDN_L4(23, 3); x23 -= l.x * x12; x23 -= l.y * x13; x23 -= l.z * x14; x23 -= l.w * x15; } { const v4f l = GDN_L4(23, 4); x23 -= l.x * x16; x23 -= l.y * x17; x23 -= l.z * x18; x23 -= l.w * x19; } { const v4f l = GDN_L4(23, 5); x23 -= l.x * x20; x23 -= l.y * x21; x23 -= l.z * x22; } __builtin_amdgcn_sched_barrier(0);
        float x24 = GDN_RHS(24); { const v4f l = GDN_L4(24, 0); x24 -= l.x * x0; x24 -= l.y * x1; x24 -= l.z * x2; x24 -= l.w * x3; } { const v4f l = GDN_L4(24, 1); x24 -= l.x * x4; x24 -= l.y * x5; x24 -= l.z * x6; x24 -= l.w * x7; } { const v4f l = GDN_L4(24, 2); x24 -= l.x * x8; x24 -= l.y * x9; x24 -= l.z * x10; x24 -= l.w * x11; } { const v4f l = GDN_L4(24, 3); x24 -= l.x * x12; x24 -= l.y * x13; x24 -= l.z * x14; x24 -= l.w * x15; } { const v4f l = GDN_L4(24, 4); x24 -= l.x * x16; x24 -= l.y * x17; x24 -= l.z * x18; x24 -= l.w * x19; } { const v4f l = GDN_L4(24, 5); x24 -= l.x * x20; x24 -= l.y * x21; x24 -= l.z * x22; x24 -= l.w * x23; } __builtin_amdgcn_sched_barrier(0);
        float x25 = GDN_RHS(25); { const v4f l = GDN_L4(25, 0); x25 -= l.x * x0; x25 -= l.y * x1; x25 -= l.z * x2; x25 -= l.w * x3; } { const v4f l = GDN_L4(25, 1); x25 -= l.x * x4; x25 -= l.y * x5; x25 -= l.z * x6; x25 -= l.w * x7; } { const v4f l = GDN_L4(25, 2); x25 -= l.x * x8; x25 -= l.y * x9; x25 -= l.z * x10; x25 -= l.w * x11; } { const v4f l = GDN_L4(25, 3); x25 -= l.x * x12; x25 -= l.y * x13; x25 -= l.z * x14; x25 -= l.w * x15; } { const v4f l = GDN_L4(25, 4); x25 -= l.x * x16; x25 -= l.y * x17; x25 -= l.z * x18; x25 -= l.w * x19; } { const v4f l = GDN_L4(25, 5); x25 -= l.x * x20; x25 -= l.y * x21; x25 -= l.z * x22; x25 -= l.w * x23; } { const v4f l = GDN_L4(25, 6); x25 -= l.x * x24; } __builtin_amdgcn_sched_barrier(0);
        float x26 = GDN_RHS(26); { const v4f l = GDN_L4(26, 0); x26 -= l.x * x0; x26 -= l.y * x1; x26 -= l.z * x2; x26 -= l.w * x3; } { const v4f l = GDN_L4(26, 1); x26 -= l.x * x4; x26 -= l.y * x5; x26 -= l.z * x6; x26 -= l.w * x7; } { const v4f l = GDN_L4(26, 2); x26 -= l.x * x8; x26 -= l.y * x9; x26 -= l.z * x10; x26 -= l.w * x11; } { const v4f l = GDN_L4(26, 3); x26 -= l.x * x12; x26 -= l.y * x13; x26 -= l.z * x14; x26 -= l.w * x15; } { const v4f l = GDN_L4(26, 4); x26 -= l.x * x16; x26 -= l.y * x17; x26 -= l.z * x18; x26 -= l.w * x19; } { const v4f l = GDN_L4(26, 5); x26 -= l.x * x20; x26 -= l.y * x21; x26 -= l.z * x22; x26 -= l.w * x23; } { const v4f l = GDN_L4(26, 6); x26 -= l.x * x24; x26 -= l.y * x25; } __builtin_amdgcn_sched_barrier(0);
        float x27 = GDN_RHS(27); { const v4f l = GDN_L4(27, 0); x27 -= l.x * x0; x27 -= l.y * x1; x27 -= l.z * x2; x27 -= l.w * x3; } { const v4f l = GDN_L4(27, 1); x27 -= l.x * x4; x27 -= l.y * x5; x27 -= l.z * x6; x27 -= l.w * x7; } { const v4f l = GDN_L4(27, 2); x27 -= l.x * x8; x27 -= l.y * x9; x27 -= l.z * x10; x27 -= l.w * x11; } { const v4f l = GDN_L4(27, 3); x27 -= l.x * x12; x27 -= l.y * x13; x27 -= l.z * x14; x27 -= l.w * x15; } { const v4f l = GDN_L4(27, 4); x27 -= l.x * x16; x27 -= l.y * x17; x27 -= l.z * x18; x27 -= l.w * x19; } { const v4f l = GDN_L4(27, 5); x27 -= l.x * x20; x27 -= l.y * x21; x27 -= l.z * x22; x27 -= l.w * x23; } { const v4f l = GDN_L4(27, 6); x27 -= l.x * x24; x27 -= l.y * x25; x27 -= l.z * x26; } __builtin_amdgcn_sched_barrier(0);
        float x28 = GDN_RHS(28); { const v4f l = GDN_L4(28, 0); x28 -= l.x * x0; x28 -= l.y * x1; x28 -= l.z * x2; x28 -= l.w * x3; } { const v4f l = GDN_L4(28, 1); x28 -= l.x * x4; x28 -= l.y * x5; x28 -= l.z * x6; x28 -= l.w * x7; } { const v4f l = GDN_L4(28, 2); x28 -= l.x * x8; x28 -= l.y * x9; x28 -= l.z * x10; x28 -= l.w * x11; } { const v4f l = GDN_L4(28, 3); x28 -= l.x * x12; x28 -= l.y * x13; x28 -= l.z * x14; x28 -= l.w * x15; } { const v4f l = GDN_L4(28, 4); x28 -= l.x * x16; x28 -= l.y * x17; x28 -= l.z * x18; x28 -= l.w * x19; } { const v4f l = GDN_L4(28, 5); x28 -= l.x * x20; x28 -= l.y * x21; x28 -= l.z * x22; x28 -= l.w * x23; } { const v4f l = GDN_L4(28, 6); x28 -= l.x * x24; x28 -= l.y * x25; x28 -= l.z * x26; x28 -= l.w * x27; } __builtin_amdgcn_sched_barrier(0);
        float x29 = GDN_RHS(29); { const v4f l = GDN_L4(29, 0); x29 -= l.x * x0; x29 -= l.y * x1; x29 -= l.z * x2; x29 -= l.w * x3; } { const v4f l = GDN_L4(29, 1); x29 -= l.x * x4; x29 -= l.y * x5; x29 -= l.z * x6; x29 -= l.w * x7; } { const v4f l = GDN_L4(29, 2); x29 -= l.x * x8; x29 -= l.y * x9; x29 -= l.z * x10; x29 -= l.w * x11; } { const v4f l = GDN_L4(29, 3); x29 -= l.x * x12; x29 -= l.y * x13; x29 -= l.z * x14; x29 -= l.w * x15; } { const v4f l = GDN_L4(29, 4); x29 -= l.x * x16; x29 -= l.y * x17; x29 -= l.z * x18; x29 -= l.w * x19; } { const v4f l = GDN_L4(29, 5); x29 -= l.x * x20; x29 -= l.y * x21; x29 -= l.z * x22; x29 -= l.w * x23; } { const v4f l = GDN_L4(29, 6); x29 -= l.x * x24; x29 -= l.y * x25; x29 -= l.z * x26; x29 -= l.w * x27; } { const v4f l = GDN_L4(29, 7); x29 -= l.x * x28; } __builtin_amdgcn_sched_barrier(0);
        float x30 = GDN_RHS(30); { const v4f l = GDN_L4(30, 0); x30 -= l.x * x0; x30 -= l.y * x1; x30 -= l.z * x2; x30 -= l.w * x3; } { const v4f l = GDN_L4(30, 1); x30 -= l.x * x4; x30 -= l.y * x5; x30 -= l.z * x6; x30 -= l.w * x7; } { const v4f l = GDN_L4(30, 2); x30 -= l.x * x8; x30 -= l.y * x9; x30 -= l.z * x10; x30 -= l.w * x11; } { const v4f l = GDN_L4(30, 3); x30 -= l.x * x12; x30 -= l.y * x13; x30 -= l.z * x14; x30 -= l.w * x15; } { const v4f l = GDN_L4(30, 4); x30 -= l.x * x16; x30 -= l.y * x17; x30 -= l.z * x18; x30 -= l.w * x19; } { const v4f l = GDN_L4(30, 5); x30 -= l.x * x20; x30 -= l.y * x21; x30 -= l.z * x22; x30 -= l.w * x23; } { const v4f l = GDN_L4(30, 6); x30 -= l.x * x24; x30 -= l.y * x25; x30 -= l.z * x26; x30 -= l.w * x27; } { const v4f l = GDN_L4(30, 7); x30 -= l.x * x28; x30 -= l.y * x29; } __builtin_amdgcn_sched_barrier(0);
        float x31 = GDN_RHS(31); { const v4f l = GDN_L4(31, 0); x31 -= l.x * x0; x31 -= l.y * x1; x31 -= l.z * x2; x31 -= l.w * x3; } { const v4f l = GDN_L4(31, 1); x31 -= l.x * x4; x31 -= l.y * x5; x31 -= l.z * x6; x31 -= l.w * x7; } { const v4f l = GDN_L4(31, 2); x31 -= l.x * x8; x31 -= l.y * x9; x31 -= l.z * x10; x31 -= l.w * x11; } { const v4f l = GDN_L4(31, 3); x31 -= l.x * x12; x31 -= l.y * x13; x31 -= l.z * x14; x31 -= l.w * x15; } { const v4f l = GDN_L4(31, 4); x31 -= l.x * x16; x31 -= l.y * x17; x31 -= l.z * x18; x31 -= l.w * x19; } { const v4f l = GDN_L4(31, 5); x31 -= l.x * x20; x31 -= l.y * x21; x31 -= l.z * x22; x31 -= l.w * x23; } { const v4f l = GDN_L4(31, 6); x31 -= l.x * x24; x31 -= l.y * x25; x31 -= l.z * x26; x31 -= l.w * x27; } { const v4f l = GDN_L4(31, 7); x31 -= l.x * x28; x31 -= l.y * x29; x31 -= l.z * x30; } __builtin_amdgcn_sched_barrier(0);
        float x32 = GDN_RHS(32); { const v4f l = GDN_L4(32, 0); x32 -= l.x * x0; x32 -= l.y * x1; x32 -= l.z * x2; x32 -= l.w * x3; } { const v4f l = GDN_L4(32, 1); x32 -= l.x * x4; x32 -= l.y * x5; x32 -= l.z * x6; x32 -= l.w * x7; } { const v4f l = GDN_L4(32, 2); x32 -= l.x * x8; x32 -= l.y * x9; x32 -= l.z * x10; x32 -= l.w * x11; } { const v4f l = GDN_L4(32, 3); x32 -= l.x * x12; x32 -= l.y * x13; x32 -= l.z * x14; x32 -= l.w * x15; } { const v4f l = GDN_L4(32, 4); x32 -= l.x * x16; x32 -= l.y * x17; x32 -= l.z * x18; x32 -= l.w * x19; } { const v4f l = GDN_L4(32, 5); x32 -= l.x * x20; x32 -= l.y * x21; x32 -= l.z * x22; x32 -= l.w * x23; } { const v4f l = GDN_L4(32, 6); x32 -= l.x * x24; x32 -= l.y * x25; x32 -= l.z * x26; x32 -= l.w * x27; } { const v4f l = GDN_L4(32, 7); x32 -= l.x * x28; x32 -= l.y * x29; x32 -= l.z * x30; x32 -= l.w * x31; } __builtin_amdgcn_sched_barrier(0);
        float x33 = GDN_RHS(33); { const v4f l = GDN_L4(33, 0); x33 -= l.x * x0; x33 -= l.y * x1; x33 -= l.z * x2; x33 -= l.w * x3; } { const v4f l = GDN_L4(33, 1); x33 -= l.x * x4; x33 -= l.y * x5; x33 -= l.z * x6; x33 -= l.w * x7; } { const v4f l = GDN_L4(33, 2); x33 -= l.x * x8; x33 -= l.y * x9; x33 -= l.z * x10; x33 -= l.w * x11; } { const v4f l = GDN_L4(33, 3); x33 -= l.x * x12; x33 -= l.y * x13; x33 -= l.z * x14; x33 -= l.w * x15; } { const v4f l = GDN_L4(33, 4); x33 -= l.x * x16; x33 -= l.y * x17; x33 -= l.z * x18; x33 -= l.w * x19; } { const v4f l = GDN_L4(33, 5); x33 -= l.x * x20; x33 -= l.y * x21; x33 -= l.z * x22; x33 -= l.w * x23; } { const v4f l = GDN_L4(33, 6); x33 -= l.x * x24; x33 -= l.y * x25; x33 -= l.z * x26; x33 -= l.w * x27; } { const v4f l = GDN_L4(33, 7); x33 -= l.x * x28; x33 -= l.y * x29; x33 -= l.z * x30; x33 -= l.w * x31; } { const v4f l = GDN_L4(33, 8); x33 -= l.x * x32; } __builtin_amdgcn_sched_barrier(0);
        float x34 = GDN_RHS(34); { const v4f l = GDN_L4(34, 0); x34 -= l.x * x0; x34 -= l.y * x1; x34 -= l.z * x2; x34 -= l.w * x3; } { const v4f l = GDN_L4(34, 1); x34 -= l.x * x4; x34 -= l.y * x5; x34 -= l.z * x6; x34 -= l.w * x7; } { const v4f l = GDN_L4(34, 2); x34 -= l.x * x8; x34 -= l.y * x9; x34 -= l.z * x10; x34 -= l.w * x11; } { const v4f l = GDN_L4(34, 3); x34 -= l.x * x12; x34 -= l.y * x13; x34 -= l.z * x14; x34 -= l.w * x15; } { const v4f l = GDN_L4(34, 4); x34 -= l.x * x16; x34 -= l.y * x17; x34 -= l.z * x18; x34 -= l.w * x19; } { const v4f l = GDN_L4(34, 5); x34 -= l.x * x20; x34 -= l.y * x21; x34 -= l.z * x22; x34 -= l.w * x23; } { const v4f l = GDN_L4(34, 6); x34 -= l.x * x24; x34 -= l.y * x25; x34 -= l.z * x26; x34 -= l.w * x27; } { const v4f l = GDN_L4(34, 7); x34 -= l.x * x28; x34 -= l.y * x29; x34 -= l.z * x30; x34 -= l.w * x31; } { const v4f l = GDN_L4(34, 8); x34 -= l.x * x32; x34 -= l.y * x33; } __builtin_amdgcn_sched_barrier(0);
        float x35 = GDN_RHS(35); { const v4f l = GDN_L4(35, 0); x35 -= l.x * x0; x35 -= l.y * x1; x35 -= l.z * x2; x35 -= l.w * x3; } { const v4f l = GDN_L4(35, 1); x35 -= l.x * x4; x35 -= l.y * x5; x35 -= l.z * x6; x35 -= l.w * x7; } { const v4f l = GDN_L4(35, 2); x35 -= l.x * x8; x35 -= l.y * x9; x35 -= l.z * x10; x35 -= l.w * x11; } { const v4f l = GDN_L4(35, 3); x35 -= l.x * x12; x35 -= l.y * x13; x35 -= l.z * x14; x35 -= l.w * x15; } { const v4f l = GDN_L4(35, 4); x35 -= l.x * x16; x35 -= l.y * x17; x35 -= l.z * x18; x35 -= l.w * x19; } { const v4f l = GDN_L4(35, 5); x35 -= l.x * x20; x35 -= l.y * x21; x35 -= l.z * x22; x35 -= l.w * x23; } { const v4f l = GDN_L4(35, 6); x35 -= l.x * x24; x35 -= l.y * x25; x35 -= l.z * x26; x35 -= l.w * x27; } { const v4f l = GDN_L4(35, 7); x35 -= l.x * x28; x35 -= l.y * x29; x35 -= l.z * x30; x35 -= l.w * x31; } { const v4f l = GDN_L4(35, 8); x35 -= l.x * x32; x35 -= l.y * x33; x35 -= l.z * x34; } __builtin_amdgcn_sched_barrier(0);
        float x36 = GDN_RHS(36); { const v4f l = GDN_L4(36, 0); x36 -= l.x * x0; x36 -= l.y * x1; x36 -= l.z * x2; x36 -= l.w * x3; } { const v4f l = GDN_L4(36, 1); x36 -= l.x * x4; x36 -= l.y * x5; x36 -= l.z * x6; x36 -= l.w * x7; } { const v4f l = GDN_L4(36, 2); x36 -= l.x * x8; x36 -= l.y * x9; x36 -= l.z * x10; x36 -= l.w * x11; } { const v4f l = GDN_L4(36, 3); x36 -= l.x * x12; x36 -= l.y * x13; x36 -= l.z * x14; x36 -= l.w * x15; } { const v4f l = GDN_L4(36, 4); x36 -= l.x * x16; x36 -= l.y * x17; x36 -= l.z * x18; x36 -= l.w * x19; } { const v4f l = GDN_L4(36, 5); x36 -= l.x * x20; x36 -= l.y * x21; x36 -= l.z * x22; x36 -= l.w * x23; } { const v4f l = GDN_L4(36, 6); x36 -= l.x * x24; x36 -= l.y * x25; x36 -= l.z * x26; x36 -= l.w * x27; } { const v4f l = GDN_L4(36, 7); x36 -= l.x * x28; x36 -= l.y * x29; x36 -= l.z * x30; x36 -= l.w * x31; } { const v4f l = GDN_L4(36, 8); x36 -= l.x * x32; x36 -= l.y * x33; x36 -= l.z * x34; x36 -= l.w * x35; } __builtin_amdgcn_sched_barrier(0);
        float x37 = GDN_RHS(37); { const v4f l = GDN_L4(37, 0); x37 -= l.x * x0; x37 -= l.y * x1; x37 -= l.z * x2; x37 -= l.w * x3; } { const v4f l = GDN_L4(37, 1); x37 -= l.x * x4; x37 -= l.y * x5; x37 -= l.z * x6; x37 -= l.w * x7; } { const v4f l = GDN_L4(37, 2); x37 -= l.x * x8; x37 -= l.y * x9; x37 -= l.z * x10; x37 -= l.w * x11; } { const v4f l = GDN_L4(37, 3); x37 -= l.x * x12; x37 -= l.y * x13; x37 -= l.z * x14; x37 -= l.w * x15; } { const v4f l = GDN_L4(37, 4); x37 -= l.x * x16; x37 -= l.y * x17; x37 -= l.z * x18; x37 -= l.w * x19; } { const v4f l = GDN_L4(37, 5); x37 -= l.x * x20; x37 -= l.y * x21; x37 -= l.z * x22; x37 -= l.w * x23; } { const v4f l = GDN_L4(37, 6); x37 -= l.x * x24; x37 -= l.y * x25; x37 -= l.z * x26; x37 -= l.w * x27; } { const v4f l = GDN_L4(37, 7); x37 -= l.x * x28; x37 -= l.y * x29; x37 -= l.z * x30; x37 -= l.w * x31; } { const v4f l = GDN_L4(37, 8); x37 -= l.x * x32; x37 -= l.y * x33; x37 -= l.z * x34; x37 -= l.w * x35; } { const v4f l = GDN_L4(37, 9); x37 -= l.x * x36; } __builtin_amdgcn_sched_barrier(0);
        float x38 = GDN_RHS(38); { const v4f l = GDN_L4(38, 0); x38 -= l.x * x0; x38 -= l.y * x1; x38 -= l.z * x2; x38 -= l.w * x3; } { const v4f l = GDN_L4(38, 1); x38 -= l.x * x4; x38 -= l.y * x5; x38 -= l.z * x6; x38 -= l.w * x7; } { const v4f l = GDN_L4(38, 2); x38 -= l.x * x8; x38 -= l.y * x9; x38 -= l.z * x10; x38 -= l.w * x11; } { const v4f l = GDN_L4(38, 3); x38 -= l.x * x12; x38 -= l.y * x13; x38 -= l.z * x14; x38 -= l.w * x15; } { const v4f l = GDN_L4(38, 4); x38 -= l.x * x16; x38 -= l.y * x17; x38 -= l.z * x18; x38 -= l.w * x19; } { const v4f l = GDN_L4(38, 5); x38 -= l.x * x20; x38 -= l.y * x21; x38 -= l.z * x22; x38 -= l.w * x23; } { const v4f l = GDN_L4(38, 6); x38 -= l.x * x24; x38 -= l.y * x25; x38 -= l.z * x26; x38 -= l.w * x27; } { const v4f l = GDN_L4(38, 7); x38 -= l.x * x28; x38 -= l.y * x29; x38 -= l.z * x30; x38 -= l.w * x31; } { const v4f l = GDN_L4(38, 8); x38 -= l.x * x32; x38 -= l.y * x33; x38 -= l.z * x34; x38 -= l.w * x35; } { const v4f l = GDN_L4(38, 9); x38 -= l.x * x36; x38 -= l.y * x37; } __builtin_amdgcn_sched_barrier(0);
        float x39 = GDN_RHS(39); { const v4f l = GDN_L4(39, 0); x39 -= l.x * x0; x39 -= l.y * x1; x39 -= l.z * x2; x39 -= l.w * x3; } { const v4f l = GDN_L4(39, 1); x39 -= l.x * x4; x39 -= l.y * x5; x39 -= l.z * x6; x39 -= l.w * x7; } { const v4f l = GDN_L4(39, 2); x39 -= l.x * x8; x39 -= l.y * x9; x39 -= l.z * x10; x39 -= l.w * x11; } { const v4f l = GDN_L4(39, 3); x39 -= l.x * x12; x39 -= l.y * x13; x39 -= l.z * x14; x39 -= l.w * x15; } { const v4f l = GDN_L4(39, 4); x39 -= l.x * x16; x39 -= l.y * x17; x39 -= l.z * x18; x39 -= l.w * x19; } { const v4f l = GDN_L4(39, 5); x39 -= l.x * x20; x39 -= l.y * x21; x39 -= l.z * x22; x39 -= l.w * x23; } { const v4f l = GDN_L4(39, 6); x39 -= l.x * x24; x39 -= l.y * x25; x39 -= l.z * x26; x39 -= l.w * x27; } { const v4f l = GDN_L4(39, 7); x39 -= l.x * x28; x39 -= l.y * x29; x39 -= l.z * x30; x39 -= l.w * x31; } { const v4f l = GDN_L4(39, 8); x39 -= l.x * x32; x39 -= l.y * x33; x39 -= l.z * x34; x39 -= l.w * x35; } { const v4f l = GDN_L4(39, 9); x39 -= l.x * x36; x39 -= l.y * x37; x39 -= l.z * x38; } __builtin_amdgcn_sched_barrier(0);
        float x40 = GDN_RHS(40); { const v4f l = GDN_L4(40, 0); x40 -= l.x * x0; x40 -= l.y * x1; x40 -= l.z * x2; x40 -= l.w * x3; } { const v4f l = GDN_L4(40, 1); x40 -= l.x * x4; x40 -= l.y * x5; x40 -= l.z * x6; x40 -= l.w * x7; } { const v4f l = GDN_L4(40, 2); x40 -= l.x * x8; x40 -= l.y * x9; x40 -= l.z * x10; x40 -= l.w * x11; } { const v4f l = GDN_L4(40, 3); x40 -= l.x * x12; x40 -= l.y * x13; x40 -= l.z * x14; x40 -= l.w * x15; } { const v4f l = GDN_L4(40, 4); x40 -= l.x * x16; x40 -= l.y * x17; x40 -= l.z * x18; x40 -= l.w * x19; } { const v4f l = GDN_L4(40, 5); x40 -= l.x * x20; x40 -= l.y * x21; x40 -= l.z * x22; x40 -= l.w * x23; } { const v4f l = GDN_L4(40, 6); x40 -= l.x * x24; x40 -= l.y * x25; x40 -= l.z * x26; x40 -= l.w * x27; } { const v4f l = GDN_L4(40, 7); x40 -= l.x * x28; x40 -= l.y * x29; x40 -= l.z * x30; x40 -= l.w * x31; } { const v4f l = GDN_L4(40, 8); x40 -= l.x * x32; x40 -= l.y * x33; x40 -= l.z * x34; x40 -= l.w * x35; } { const v4f l = GDN_L4(40, 9); x40 -= l.x * x36; x40 -= l.y * x37; x40 -= l.z * x38; x40 -= l.w * x39; } __builtin_amdgcn_sched_barrier(0);
        float x41 = GDN_RHS(41); { const v4f l = GDN_L4(41, 0); x41 -= l.x * x0; x41 -= l.y * x1; x41 -= l.z * x2; x41 -= l.w * x3; } { const v4f l = GDN_L4(41, 1); x41 -= l.x * x4; x41 -= l.y * x5; x41 -= l.z * x6; x41 -= l.w * x7; } { const v4f l = GDN_L4(41, 2); x41 -= l.x * x8; x41 -= l.y * x9; x41 -= l.z * x10; x41 -= l.w * x11; } { const v4f l = GDN_L4(41, 3); x41 -= l.x * x12; x41 -= l.y * x13; x41 -= l.z * x14; x41 -= l.w * x15; } { const v4f l = GDN_L4(41, 4); x41 -= l.x * x16; x41 -= l.y * x17; x41 -= l.z * x18; x41 -= l.w * x19; } { const v4f l = GDN_L4(41, 5); x41 -= l.x * x20; x41 -= l.y * x21; x41 -= l.z * x22; x41 -= l.w * x23; } { const v4f l = GDN_L4(41, 6); x41 -= l.x * x24; x41 -= l.y * x25; x41 -= l.z * x26; x41 -= l.w * x27; } { const v4f l = GDN_L4(41, 7); x41 -= l.x * x28; x41 -= l.y * x29; x41 -= l.z * x30; x41 -= l.w * x31; } { const v4f l = GDN_L4(41, 8); x41 -= l.x * x32; x41 -= l.y * x33; x41 -= l.z * x34; x41 -= l.w * x35; } { const v4f l = GDN_L4(41, 9); x41 -= l.x * x36; x41 -= l.y * x37; x41 -= l.z * x38; x41 -= l.w * x39; } { const v4f l = GDN_L4(41, 10); x41 -= l.x * x40; } __builtin_amdgcn_sched_barrier(0);
        float x42 = GDN_RHS(42); { const v4f l = GDN_L4(42, 0); x42 -= l.x * x0; x42 -= l.y * x1; x42 -= l.z * x2; x42 -= l.w * x3; } { const v4f l = GDN_L4(42, 1); x42 -= l.x * x4; x42 -= l.y * x5; x42 -= l.z * x6; x42 -= l.w * x7; } { const v4f l = GDN_L4(42, 2); x42 -= l.x * x8; x42 -= l.y * x9; x42 -= l.z * x10; x42 -= l.w * x11; } { const v4f l = GDN_L4(42, 3); x42 -= l.x * x12; x42 -= l.y * x13; x42 -= l.z * x14; x42 -= l.w * x15; } { const v4f l = GDN_L4(42, 4); x42 -= l.x * x16; x42 -= l.y * x17; x42 -= l.z * x18; x42 -= l.w * x19; } { const v4f l = GDN_L4(42, 5); x42 -= l.x * x20; x42 -= l.y * x21; x42 -= l.z * x22; x42 -= l.w * x23; } { const v4f l = GDN_L4(42, 6); x42 -= l.x * x24; x42 -= l.y * x25; x42 -= l.z * x26; x42 -= l.w * x27; } { const v4f l = GDN_L4(42, 7); x42 -= l.x * x28; x42 -= l.y * x29; x42 -= l.z * x30; x42 -= l.w * x31; } { const v4f l = GDN_L4(42, 8); x42 -= l.x * x32; x42 -= l.y * x33; x42 -= l.z * x34; x42 -= l.w * x35; } { const v4f l = GDN_L4(42, 9); x42 -= l.x * x36; x42 -= l.y * x37; x42 -= l.z * x38; x42 -= l.w * x39; } { const v4f l = GDN_L4(42, 10); x42 -= l.x * x40; x42 -= l.y * x41; } __builtin_amdgcn_sched_barrier(0);
        float x43 = GDN_RHS(43); { const v4f l = GDN_L4(43, 0); x43 -= l.x * x0; x43 -= l.y * x1; x43 -= l.z * x2; x43 -= l.w * x3; } { const v4f l = GDN_L4(43, 1); x43 -= l.x * x4; x43 -= l.y * x5; x43 -= l.z * x6; x43 -= l.w * x7; } { const v4f l = GDN_L4(43, 2); x43 -= l.x * x8; x43 -= l.y * x9; x43 -= l.z * x10; x43 -= l.w * x11; } { const v4f l = GDN_L4(43, 3); x43 -= l.x * x12; x43 -= l.y * x13; x43 -= l.z * x14; x43 -= l.w * x15; } { const v4f l = GDN_L4(43, 4); x43 -= l.x * x16; x43 -= l.y * x17; x43 -= l.z * x18; x43 -= l.w * x19; } { const v4f l = GDN_L4(43, 5); x43 -= l.x * x20; x43 -= l.y * x21; x43 -= l.z * x22; x43 -= l.w * x23; } { const v4f l = GDN_L4(43, 6); x43 -= l.x * x24; x43 -= l.y * x25; x43 -= l.z * x26; x43 -= l.w * x27; } { const v4f l = GDN_L4(43, 7); x43 -= l.x * x28; x43 -= l.y * x29; x43 -= l.z * x30; x43 -= l.w * x31; } { const v4f l = GDN_L4(43, 8); x43 -= l.x * x32; x43 -= l.y * x33; x43 -= l.z * x34; x43 -= l.w * x35; } { const v4f l = GDN_L4(43, 9); x43 -= l.x * x36; x43 -= l.y * x37; x43 -= l.z * x38; x43 -= l.w * x39; } { const v4f l = GDN_L4(43, 10); x43 -= l.x * x40; x43 -= l.y * x41; x43 -= l.z * x42; } __builtin_amdgcn_sched_barrier(0);
        float x44 = GDN_RHS(44); { const v4f l = GDN_L4(44, 0); x44 -= l.x * x0; x44 -= l.y * x1; x44 -= l.z * x2; x44 -= l.w * x3; } { const v4f l = GDN_L4(44, 1); x44 -= l.x * x4; x44 -= l.y * x5; x44 -= l.z * x6; x44 -= l.w * x7; } { const v4f l = GDN_L4(44, 2); x44 -= l.x * x8; x44 -= l.y * x9; x44 -= l.z * x10; x44 -= l.w * x11; } { const v4f l = GDN_L4(44, 3); x44 -= l.x * x12; x44 -= l.y * x13; x44 -= l.z * x14; x44 -= l.w * x15; } { const v4f l = GDN_L4(44, 4); x44 -= l.x * x16; x44 -= l.y * x17; x44 -= l.z * x18; x44 -= l.w * x19; } { const v4f l = GDN_L4(44, 5); x44 -= l.x * x20; x44 -= l.y * x21; x44 -= l.z * x22; x44 -= l.w * x23; } { const v4f l = GDN_L4(44, 6); x44 -= l.x * x24; x44 -= l.y * x25; x44 -= l.z * x26; x44 -= l.w * x27; } { const v4f l = GDN_L4(44, 7); x44 -= l.x * x28; x44 -= l.y * x29; x44 -= l.z * x30; x44 -= l.w * x31; } { const v4f l = GDN_L4(44, 8); x44 -= l.x * x32; x44 -= l.y * x33; x44 -= l.z * x34; x44 -= l.w * x35; } { const v4f l = GDN_L4(44, 9); x44 -= l.x * x36; x44 -= l.y * x37; x44 -= l.z * x38; x44 -= l.w * x39; } { const v4f l = GDN_L4(44, 10); x44 -= l.x * x40; x44 -= l.y * x41; x44 -= l.z * x42; x44 -= l.w * x43; } __builtin_amdgcn_sched_barrier(0);
        float x45 = GDN_RHS(45); { const v4f l = GDN_L4(45, 0); x45 -= l.x * x0; x45 -= l.y * x1; x45 -= l.z * x2; x45 -= l.w * x3; } { const v4f l = GDN_L4(45, 1); x45 -= l.x * x4; x45 -= l.y * x5; x45 -= l.z * x6; x45 -= l.w * x7; } { const v4f l = GDN_L4(45, 2); x45 -= l.x * x8; x45 -= l.y * x9; x45 -= l.z * x10; x45 -= l.w * x11; } { const v4f l = GDN_L4(45, 3); x45 -= l.x * x12; x45 -= l.y * x13; x45 -= l.z * x14; x45 -= l.w * x15; } { const v4f l = GDN_L4(45, 4); x45 -= l.x * x16; x45 -= l.y * x17; x45 -= l.z * x18; x45 -= l.w * x19; } { const v4f l = GDN_L4(45, 5); x45 -= l.x * x20; x45 -= l.y * x21; x45 -= l.z * x22; x45 -= l.w * x23; } { const v4f l = GDN_L4(45, 6); x45 -= l.x * x24; x45 -= l.y * x25; x45 -= l.z * x26; x45 -= l.w * x27; } { const v4f l = GDN_L4(45, 7); x45 -= l.x * x28; x45 -= l.y * x29; x45 -= l.z * x30; x45 -= l.w * x31; } { const v4f l = GDN_L4(45, 8); x45 -= l.x * x32; x45 -= l.y * x33; x45 -= l.z * x34; x45 -= l.w * x35; } { const v4f l = GDN_L4(45, 9); x45 -= l.x * x36; x45 -= l.y * x37; x45 -= l.z * x38; x45 -= l.w * x39; } { const v4f l = GDN_L4(45, 10); x45 -= l.x * x40; x45 -= l.y * x41; x45 -= l.z * x42; x45 -= l.w * x43; } { const v4f l = GDN_L4(45, 11); x45 -= l.x * x44; } __builtin_amdgcn_sched_barrier(0);
        float x46 = GDN_RHS(46); { const v4f l = GDN_L4(46, 0); x46 -= l.x * x0; x46 -= l.y * x1; x46 -= l.z * x2; x46 -= l.w * x3; } { const v4f l = GDN_L4(46, 1); x46 -= l.x * x4; x46 -= l.y * x5; x46 -= l.z * x6; x46 -= l.w * x7; } { const v4f l = GDN_L4(46, 2); x46 -= l.x * x8; x46 -= l.y * x9; x46 -= l.z * x10; x46 -= l.w * x11; } { const v4f l = GDN_L4(46, 3); x46 -= l.x * x12; x46 -= l.y * x13; x46 -= l.z * x14; x46 -= l.w * x15; } { const v4f l = GDN_L4(46, 4); x46 -= l.x * x16; x46 -= l.y * x17; x46 -= l.z * x18; x46 -= l.w * x19; } { const v4f l = GDN_L4(46, 5); x46 -= l.x * x20; x46 -= l.y * x21; x46 -= l.z * x22; x46 -= l.w * x23; } { const v4f l = GDN_L4(46, 6); x46 -= l.x * x24; x46 -= l.y * x25; x46 -= l.z * x26; x46 -= l.w * x27; } { const v4f l = GDN_L4(46, 7); x46 -= l.x * x28; x46 -= l.y * x29; x46 -= l.z * x30; x46 -= l.w * x31; } { const v4f l = GDN_L4(46, 8); x46 -= l.x * x32; x46 -= l.y * x33; x46 -= l.z * x34; x46 -= l.w * x35; } { const v4f l = GDN_L4(46, 9); x46 -= l.x * x36; x46 -= l.y * x37; x46 -= l.z * x38; x46 -= l.w * x39; } { const v4f l = GDN_L4(46, 10); x46 -= l.x * x40; x46 -= l.y * x41; x46 -= l.z * x42; x46 -= l.w * x43; } { const v4f l = GDN_L4(46, 11); x46 -= l.x * x44; x46 -= l.y * x45; } __builtin_amdgcn_sched_barrier(0);
        float x47 = GDN_RHS(47); { const v4f l = GDN_L4(47, 0); x47 -= l.x * x0; x47 -= l.y * x1; x47 -= l.z * x2; x47 -= l.w * x3; } { const v4f l = GDN_L4(47, 1); x47 -= l.x * x4; x47 -= l.y * x5; x47 -= l.z * x6; x47 -= l.w * x7; } { const v4f l = GDN_L4(47, 2); x47 -= l.x * x8; x47 -= l.y * x9; x47 -= l.z * x10; x47 -= l.w * x11; } { const v4f l = GDN_L4(47, 3); x47 -= l.x * x12; x47 -= l.y * x13; x47 -= l.z * x14; x47 -= l.w * x15; } { const v4f l = GDN_L4(47, 4); x47 -= l.x * x16; x47 -= l.y * x17; x47 -= l.z * x18; x47 -= l.w * x19; } { const v4f l = GDN_L4(47, 5); x47 -= l.x * x20; x47 -= l.y * x21; x47 -= l.z * x22; x47 -= l.w * x23; } { const v4f l = GDN_L4(47, 6); x47 -= l.x * x24; x47 -= l.y * x25; x47 -= l.z * x26; x47 -= l.w * x27; } { const v4f l = GDN_L4(47, 7); x47 -= l.x * x28; x47 -= l.y * x29; x47 -= l.z * x30; x47 -= l.w * x31; } { const v4f l = GDN_L4(47, 8); x47 -= l.x * x32; x47 -= l.y * x33; x47 -= l.z * x34; x47 -= l.w * x35; } { const v4f l = GDN_L4(47, 9); x47 -= l.x * x36; x47 -= l.y * x37; x47 -= l.z * x38; x47 -= l.w * x39; } { const v4f l = GDN_L4(47, 10); x47 -= l.x * x40; x47 -= l.y * x41; x47 -= l.z * x42; x47 -= l.w * x43; } { const v4f l = GDN_L4(47, 11); x47 -= l.x * x44; x47 -= l.y * x45; x47 -= l.z * x46; } __builtin_amdgcn_sched_barrier(0);
        float x48 = GDN_RHS(48); { const v4f l = GDN_L4(48, 0); x48 -= l.x * x0; x48 -= l.y * x1; x48 -= l.z * x2; x48 -= l.w * x3; } { const v4f l = GDN_L4(48, 1); x48 -= l.x * x4; x48 -= l.y * x5; x48 -= l.z * x6; x48 -= l.w * x7; } { const v4f l = GDN_L4(48, 2); x48 -= l.x * x8; x48 -= l.y * x9; x48 -= l.z * x10; x48 -= l.w * x11; } { const v4f l = GDN_L4(48, 3); x48 -= l.x * x12; x48 -= l.y * x13; x48 -= l.z * x14; x48 -= l.w * x15; } { const v4f l = GDN_L4(48, 4); x48 -= l.x * x16; x48 -= l.y * x17; x48 -= l.z * x18; x48 -= l.w * x19; } { const v4f l = GDN_L4(48, 5); x48 -= l.x * x20; x48 -= l.y * x21; x48 -= l.z * x22; x48 -= l.w * x23; } { const v4f l = GDN_L4(48, 6); x48 -= l.x * x24; x48 -= l.y * x25; x48 -= l.z * x26; x48 -= l.w * x27; } { const v4f l = GDN_L4(48, 7); x48 -= l.x * x28; x48 -= l.y * x29; x48 -= l.z * x30; x48 -= l.w * x31; } { const v4f l = GDN_L4(48, 8); x48 -= l.x * x32; x48 -= l.y * x33; x48 -= l.z * x34; x48 -= l.w * x35; } { const v4f l = GDN_L4(48, 9); x48 -= l.x * x36; x48 -= l.y * x37; x48 -= l.z * x38; x48 -= l.w * x39; } { const v4f l = GDN_L4(48, 10); x48 -= l.x * x40; x48 -= l.y * x41; x48 -= l.z * x42; x48 -= l.w * x43; } { const v4f l = GDN_L4(48, 11); x48 -= l.x * x44; x48 -= l.y * x45; x48 -= l.z * x46; x48 -= l.w * x47; } __builtin_amdgcn_sched_barrier(0);
        float x49 = GDN_RHS(49); { const v4f l = GDN_L4(49, 0); x49 -= l.x * x0; x49 -= l.y * x1; x49 -= l.z * x2; x49 -= l.w * x3; } { const v4f l = GDN_L4(49, 1); x49 -= l.x * x4; x49 -= l.y * x5; x49 -= l.z * x6; x49 -= l.w * x7; } { const v4f l = GDN_L4(49, 2); x49 -= l.x * x8; x49 -= l.y * x9; x49 -= l.z * x10; x49 -= l.w * x11; } { const v4f l = GDN_L4(49, 3); x49 -= l.x * x12; x49 -= l.y * x13; x49 -= l.z * x14; x49 -= l.w * x15; } { const v4f l = GDN_L4(49, 4); x49 -= l.x * x16; x49 -= l.y * x17; x49 -= l.z * x18; x49 -= l.w * x19; } { const v4f l = GDN_L4(49, 5); x49 -= l.x * x20; x49 -= l.y * x21; x49 -= l.z * x22; x49 -= l.w * x23; } { const v4f l = GDN_L4(49, 6); x49 -= l.x * x24; x49 -= l.y * x25; x49 -= l.z * x26; x49 -= l.w * x27; } { const v4f l = GDN_L4(49, 7); x49 -= l.x * x28; x49 -= l.y * x29; x49 -= l.z * x30; x49 -= l.w * x31; } { const v4f l = GDN_L4(49, 8); x49 -= l.x * x32; x49 -= l.y * x33; x49 -= l.z * x34; x49 -= l.w * x35; } { const v4f l = GDN_L4(49, 9); x49 -= l.x * x36; x49 -= l.y * x37; x49 -= l.z * x38; x49 -= l.w * x39; } { const v4f l = GDN_L4(49, 10); x49 -= l.x * x40; x49 -= l.y * x41; x49 -= l.z * x42; x49 -= l.w * x43; } { const v4f l = GDN_L4(49, 11); x49 -= l.x * x44; x49 -= l.y * x45; x49 -= l.z * x46; x49 -= l.w * x47; } { const v4f l = GDN_L4(49, 12); x49 -= l.x * x48; } __builtin_amdgcn_sched_barrier(0);
        float x50 = GDN_RHS(50); { const v4f l = GDN_L4(50, 0); x50 -= l.x * x0; x50 -= l.y * x1; x50 -= l.z * x2; x50 -= l.w * x3; } { const v4f l = GDN_L4(50, 1); x50 -= l.x * x4; x50 -= l.y * x5; x50 -= l.z * x6; x50 -= l.w * x7; } { const v4f l = GDN_L4(50, 2); x50 -= l.x * x8; x50 -= l.y * x9; x50 -= l.z * x10; x50 -= l.w * x11; } { const v4f l = GDN_L4(50, 3); x50 -= l.x * x12; x50 -= l.y * x13; x50 -= l.z * x14; x50 -= l.w * x15; } { const v4f l = GDN_L4(50, 4); x50 -= l.x * x16; x50 -= l.y * x17; x50 -= l.z * x18; x50 -= l.w * x19; } { const v4f l = GDN_L4(50, 5); x50 -= l.x * x20; x50 -= l.y * x21; x50 -= l.z * x22; x50 -= l.w * x23; } { const v4f l = GDN_L4(50, 6); x50 -= l.x * x24; x50 -= l.y * x25; x50 -= l.z * x26; x50 -= l.w * x27; } { const v4f l = GDN_L4(50, 7); x50 -= l.x * x28; x50 -= l.y * x29; x50 -= l.z * x30; x50 -= l.w * x31; } { const v4f l = GDN_L4(50, 8); x50 -= l.x * x32; x50 -= l.y * x33; x50 -= l.z * x34; x50 -= l.w * x35; } { const v4f l = GDN_L4(50, 9); x50 -= l.x * x36; x50 -= l.y * x37; x50 -= l.z * x38; x50 -= l.w * x39; } { const v4f l = GDN_L4(50, 10); x50 -= l.x * x40; x50 -= l.y * x41; x50 -= l.z * x42; x50 -= l.w * x43; } { const v4f l = GDN_L4(50, 11); x50 -= l.x * x44; x50 -= l.y * x45; x50 -= l.z * x46; x50 -= l.w * x47; } { const v4f l = GDN_L4(50, 12); x50 -= l.x * x48; x50 -= l.y * x49; } __builtin_amdgcn_sched_barrier(0);
        float x51 = GDN_RHS(51); { const v4f l = GDN_L4(51, 0); x51 -= l.x * x0; x51 -= l.y * x1; x51 -= l.z * x2; x51 -= l.w * x3; } { const v4f l = GDN_L4(51, 1); x51 -= l.x * x4; x51 -= l.y * x5; x51 -= l.z * x6; x51 -= l.w * x7; } { const v4f l = GDN_L4(51, 2); x51 -= l.x * x8; x51 -= l.y * x9; x51 -= l.z * x10; x51 -= l.w * x11; } { const v4f l = GDN_L4(51, 3); x51 -= l.x * x12; x51 -= l.y * x13; x51 -= l.z * x14; x51 -= l.w * x15; } { const v4f l = GDN_L4(51, 4); x51 -= l.x * x16; x51 -= l.y * x17; x51 -= l.z * x18; x51 -= l.w * x19; } { const v4f l = GDN_L4(51, 5); x51 -= l.x * x20; x51 -= l.y * x21; x51 -= l.z * x22; x51 -= l.w * x23; } { const v4f l = GDN_L4(51, 6); x51 -= l.x * x24; x51 -= l.y * x25; x51 -= l.z * x26; x51 -= l.w * x27; } { const v4f l = GDN_L4(51, 7); x51 -= l.x * x28; x51 -= l.y * x29; x51 -= l.z * x30; x51 -= l.w * x31; } { const v4f l = GDN_L4(51, 8); x51 -= l.x * x32; x51 -= l.y * x33; x51 -= l.z * x34; x51 -= l.w * x35; } { const v4f l = GDN_L4(51, 9); x51 -= l.x * x36; x51 -= l.y * x37; x51 -= l.z * x38; x51 -= l.w * x39; } { const v4f l = GDN_L4(51, 10); x51 -= l.x * x40; x51 -= l.y * x41; x51 -= l.z * x42; x51 -= l.w * x43; } { const v4f l = GDN_L4(51, 11); x51 -= l.x * x44; x51 -= l.y * x45; x51 -= l.z * x46; x51 -= l.w * x47; } { const v4f l = GDN_L4(51, 12); x51 -= l.x * x48; x51 -= l.y * x49; x51 -= l.z * x50; } __builtin_amdgcn_sched_barrier(0);
        float x52 = GDN_RHS(52); { const v4f l = GDN_L4(52, 0); x52 -= l.x * x0; x52 -= l.y * x1; x52 -= l.z * x2; x52 -= l.w * x3; } { const v4f l = GDN_L4(52, 1); x52 -= l.x * x4; x52 -= l.y * x5; x52 -= l.z * x6; x52 -= l.w * x7; } { const v4f l = GDN_L4(52, 2); x52 -= l.x * x8; x52 -= l.y * x9; x52 -= l.z * x10; x52 -= l.w * x11; } { const v4f l = GDN_L4(52, 3); x52 -= l.x * x12; x52 -= l.y * x13; x52 -= l.z * x14; x52 -= l.w * x15; } { const v4f l = GDN_L4(52, 4); x52 -= l.x * x16; x52 -= l.y * x17; x52 -= l.z * x18; x52 -= l.w * x19; } { const v4f l = GDN_L4(52, 5); x52 -= l.x * x20; x52 -= l.y * x21; x52 -= l.z * x22; x52 -= l.w * x23; } { const v4f l = GDN_L4(52, 6); x52 -= l.x * x24; x52 -= l.y * x25; x52 -= l.z * x26; x52 -= l.w * x27; } { const v4f l = GDN_L4(52, 7); x52 -= l.x * x28; x52 -= l.y * x29; x52 -= l.z * x30; x52 -= l.w * x31; } { const v4f l = GDN_L4(52, 8); x52 -= l.x * x32; x52 -= l.y * x33; x52 -= l.z * x34; x52 -= l.w * x35; } { const v4f l = GDN_L4(52, 9); x52 -= l.x * x36; x52 -= l.y * x37; x52 -= l.z * x38; x52 -= l.w * x39; } { const v4f l = GDN_L4(52, 10); x52 -= l.x * x40; x52 -= l.y * x41; x52 -= l.z * x42; x52 -= l.w * x43; } { const v4f l = GDN_L4(52, 11); x52 -= l.x * x44; x52 -= l.y * x45; x52 -= l.z * x46; x52 -= l.w * x47; } { const v4f l = GDN_L4(52, 12); x52 -= l.x * x48; x52 -= l.y * x49; x52 -= l.z * x50; x52 -= l.w * x51; } __builtin_amdgcn_sched_barrier(0);
        float x53 = GDN_RHS(53); { const v4f l = GDN_L4(53, 0); x53 -= l.x * x0; x53 -= l.y * x1; x53 -= l.z * x2; x53 -= l.w * x3; } { const v4f l = GDN_L4(53, 1); x53 -= l.x * x4; x53 -= l.y * x5; x53 -= l.z * x6; x53 -= l.w * x7; } { const v4f l = GDN_L4(53, 2); x53 -= l.x * x8; x53 -= l.y * x9; x53 -= l.z * x10; x53 -= l.w * x11; } { const v4f l = GDN_L4(53, 3); x53 -= l.x * x12; x53 -= l.y * x13; x53 -= l.z * x14; x53 -= l.w * x15; } { const v4f l = GDN_L4(53, 4); x53 -= l.x * x16; x53 -= l.y * x17; x53 -= l.z * x18; x53 -= l.w * x19; } { const v4f l = GDN_L4(53, 5); x53 -= l.x * x20; x53 -= l.y * x21; x53 -= l.z * x22; x53 -= l.w * x23; } { const v4f l = GDN_L4(53, 6); x53 -= l.x * x24; x53 -= l.y * x25; x53 -= l.z * x26; x53 -= l.w * x27; } { const v4f l = GDN_L4(53, 7); x53 -= l.x * x28; x53 -= l.y * x29; x53 -= l.z * x30; x53 -= l.w * x31; } { const v4f l = GDN_L4(53, 8); x53 -= l.x * x32; x53 -= l.y * x33; x53 -= l.z * x34; x53 -= l.w * x35; } { const v4f l = GDN_L4(53, 9); x53 -= l.x * x36; x53 -= l.y * x37; x53 -= l.z * x38; x53 -= l.w * x39; } { const v4f l = GDN_L4(53, 10); x53 -= l.x * x40; x53 -= l.y * x41; x53 -= l.z * x42; x53 -= l.w * x43; } { const v4f l = GDN_L4(53, 11); x53 -= l.x * x44; x53 -= l.y * x45; x53 -= l.z * x46; x53 -= l.w * x47; } { const v4f l = GDN_L4(53, 12); x53 -= l.x * x48; x53 -= l.y * x49; x53 -= l.z * x50; x53 -= l.w * x51; } { const v4f l = GDN_L4(53, 13); x53 -= l.x * x52; } __builtin_amdgcn_sched_barrier(0);
        float x54 = GDN_RHS(54); { const v4f l = GDN_L4(54, 0); x54 -= l.x * x0; x54 -= l.y * x1; x54 -= l.z * x2; x54 -= l.w * x3; } { const v4f l = GDN_L4(54, 1); x54 -= l.x * x4; x54 -= l.y * x5; x54 -= l.z * x6; x54 -= l.w * x7; } { const v4f l = GDN_L4(54, 2); x54 -= l.x * x8; x54 -= l.y * x9; x54 -= l.z * x10; x54 -= l.w * x11; } { const v4f l = GDN_L4(54, 3); x54 -= l.x * x12; x54 -= l.y * x13; x54 -= l.z * x14; x54 -= l.w * x15; } { const v4f l = GDN_L4(54, 4); x54 -= l.x * x16; x54 -= l.y * x17; x54 -= l.z * x18; x54 -= l.w * x19; } { const v4f l = GDN_L4(54, 5); x54 -= l.x * x20; x54 -= l.y * x21; x54 -= l.z * x22; x54 -= l.w * x23; } { const v4f l = GDN_L4(54, 6); x54 -= l.x * x24; x54 -= l.y * x25; x54 -= l.z * x26; x54 -= l.w * x27; } { const v4f l = GDN_L4(54, 7); x54 -= l.x * x28; x54 -= l.y * x29; x54 -= l.z * x30; x54 -= l.w * x31; } { const v4f l = GDN_L4(54, 8); x54 -= l.x * x32; x54 -= l.y * x33; x54 -= l.z * x34; x54 -= l.w * x35; } { const v4f l = GDN_L4(54, 9); x54 -= l.x * x36; x54 -= l.y * x37; x54 -= l.z * x38; x54 -= l.w * x39; } { const v4f l = GDN_L4(54, 10); x54 -= l.x * x40; x54 -= l.y * x41; x54 -= l.z * x42; x54 -= l.w * x43; } { const v4f l = GDN_L4(54, 11); x54 -= l.x * x44; x54 -= l.y * x45; x54 -= l.z * x46; x54 -= l.w * x47; } { const v4f l = GDN_L4(54, 12); x54 -= l.x * x48; x54 -= l.y * x49; x54 -= l.z * x50; x54 -= l.w * x51; } { const v4f l = GDN_L4(54, 13); x54 -= l.x * x52; x54 -= l.y * x53; } __builtin_amdgcn_sched_barrier(0);
        float x55 = GDN_RHS(55); { const v4f l = GDN_L4(55, 0); x55 -= l.x * x0; x55 -= l.y * x1; x55 -= l.z * x2; x55 -= l.w * x3; } { const v4f l = GDN_L4(55, 1); x55 -= l.x * x4; x55 -= l.y * x5; x55 -= l.z * x6; x55 -= l.w * x7; } { const v4f l = GDN_L4(55, 2); x55 -= l.x * x8; x55 -= l.y * x9; x55 -= l.z * x10; x55 -= l.w * x11; } { const v4f l = GDN_L4(55, 3); x55 -= l.x * x12; x55 -= l.y * x13; x55 -= l.z * x14; x55 -= l.w * x15; } { const v4f l = GDN_L4(55, 4); x55 -= l.x * x16; x55 -= l.y * x17; x55 -= l.z * x18; x55 -= l.w * x19; } { const v4f l = GDN_L4(55, 5); x55 -= l.x * x20; x55 -= l.y * x21; x55 -= l.z * x22; x55 -= l.w * x23; } { const v4f l = GDN_L4(55, 6); x55 -= l.x * x24; x55 -= l.y * x25; x55 -= l.z * x26; x55 -= l.w * x27; } { const v4f l = GDN_L4(55, 7); x55 -= l.x * x28; x55 -= l.y * x29; x55 -= l.z * x30; x55 -= l.w * x31; } { const v4f l = GDN_L4(55, 8); x55 -= l.x * x32; x55 -= l.y * x33; x55 -= l.z * x34; x55 -= l.w * x35; } { const v4f l = GDN_L4(55, 9); x55 -= l.x * x36; x55 -= l.y * x37; x55 -= l.z * x38; x55 -= l.w * x39; } { const v4f l = GDN_L4(55, 10); x55 -= l.x * x40; x55 -= l.y * x41; x55 -= l.z * x42; x55 -= l.w * x43; } { const v4f l = GDN_L4(55, 11); x55 -= l.x * x44; x55 -= l.y * x45; x55 -= l.z * x46; x55 -= l.w * x47; } { const v4f l = GDN_L4(55, 12); x55 -= l.x * x48; x55 -= l.y * x49; x55 -= l.z * x50; x55 -= l.w * x51; } { const v4f l = GDN_L4(55, 13); x55 -= l.x * x52; x55 -= l.y * x53; x55 -= l.z * x54; } __builtin_amdgcn_sched_barrier(0);
        float x56 = GDN_RHS(56); { const v4f l = GDN_L4(56, 0); x56 -= l.x * x0; x56 -= l.y * x1; x56 -= l.z * x2; x56 -= l.w * x3; } { const v4f l = GDN_L4(56, 1); x56 -= l.x * x4; x56 -= l.y * x5; x56 -= l.z * x6; x56 -= l.w * x7; } { const v4f l = GDN_L4(56, 2); x56 -= l.x * x8; x56 -= l.y * x9; x56 -= l.z * x10; x56 -= l.w * x11; } { const v4f l = GDN_L4(56, 3); x56 -= l.x * x12; x56 -= l.y * x13; x56 -= l.z * x14; x56 -= l.w * x15; } { const v4f l = GDN_L4(56, 4); x56 -= l.x * x16; x56 -= l.y * x17; x56 -= l.z * x18; x56 -= l.w * x19; } { const v4f l = GDN_L4(56, 5); x56 -= l.x * x20; x56 -= l.y * x21; x56 -= l.z * x22; x56 -= l.w * x23; } { const v4f l = GDN_L4(56, 6); x56 -= l.x * x24; x56 -= l.y * x25; x56 -= l.z * x26; x56 -= l.w * x27; } { const v4f l = GDN_L4(56, 7); x56 -= l.x * x28; x56 -= l.y * x29; x56 -= l.z * x30; x56 -= l.w * x31; } { const v4f l = GDN_L4(56, 8); x56 -= l.x * x32; x56 -= l.y * x33; x56 -= l.z * x34; x56 -= l.w * x35; } { const v4f l = GDN_L4(56, 9); x56 -= l.x * x36; x56 -= l.y * x37; x56 -= l.z * x38; x56 -= l.w * x39; } { const v4f l = GDN_L4(56, 10); x56 -= l.x * x40; x56 -= l.y * x41; x56 -= l.z * x42; x56 -= l.w * x43; } { const v4f l = GDN_L4(56, 11); x56 -= l.x * x44; x56 -= l.y * x45; x56 -= l.z * x46; x56 -= l.w * x47; } { const v4f l = GDN_L4(56, 12); x56 -= l.x * x48; x56 -= l.y * x49; x56 -= l.z * x50; x56 -= l.w * x51; } { const v4f l = GDN_L4(56, 13); x56 -= l.x * x52; x56 -= l.y * x53; x56 -= l.z * x54; x56 -= l.w * x55; } __builtin_amdgcn_sched_barrier(0);
        float x57 = GDN_RHS(57); { const v4f l = GDN_L4(57, 0); x57 -= l.x * x0; x57 -= l.y * x1; x57 -= l.z * x2; x57 -= l.w * x3; } { const v4f l = GDN_L4(57, 1); x57 -= l.x * x4; x57 -= l.y * x5; x57 -= l.z * x6; x57 -= l.w * x7; } { const v4f l = GDN_L4(57, 2); x57 -= l.x * x8; x57 -= l.y * x9; x57 -= l.z * x10; x57 -= l.w * x11; } { const v4f l = GDN_L4(57, 3); x57 -= l.x * x12; x57 -= l.y * x13; x57 -= l.z * x14; x57 -= l.w * x15; } { const v4f l = GDN_L4(57, 4); x57 -= l.x * x16; x57 -= l.y * x17; x57 -= l.z * x18; x57 -= l.w * x19; } { const v4f l = GDN_L4(57, 5); x57 -= l.x * x20; x57 -= l.y * x21; x57 -= l.z * x22; x57 -= l.w * x23; } { const v4f l = GDN_L4(57, 6); x57 -= l.x * x24; x57 -= l.y * x25; x57 -= l.z * x26; x57 -= l.w * x27; } { const v4f l = GDN_L4(57, 7); x57 -= l.x * x28; x57 -= l.y * x29; x57 -= l.z * x30; x57 -= l.w * x31; } { const v4f l = GDN_L4(57, 8); x57 -= l.x * x32; x57 -= l.y * x33; x57 -= l.z * x34; x57 -= l.w * x35; } { const v4f l = GDN_L4(57, 9); x57 -= l.x * x36; x57 -= l.y * x37; x57 -= l.z * x38; x57 -= l.w * x39; } { const v4f l = GDN_L4(57, 10); x57 -= l.x * x40; x57 -= l.y * x41; x57 -= l.z * x42; x57 -= l.w * x43; } { const v4f l = GDN_L4(57, 11); x57 -= l.x * x44; x57 -= l.y * x45; x57 -= l.z * x46; x57 -= l.w * x47; } { const v4f l = GDN_L4(57, 12); x57 -= l.x * x48; x57 -= l.y * x49; x57 -= l.z * x50; x57 -= l.w * x51; } { const v4f l = GDN_L4(57, 13); x57 -= l.x * x52; x57 -= l.y * x53; x57 -= l.z * x54; x57 -= l.w * x55; } { const v4f l = GDN_L4(57, 14); x57 -= l.x * x56; } __builtin_amdgcn_sched_barrier(0);
        float x58 = GDN_RHS(58); { const v4f l = GDN_L4(58, 0); x58 -= l.x * x0; x58 -= l.y * x1; x58 -= l.z * x2; x58 -= l.w * x3; } { const v4f l = GDN_L4(58, 1); x58 -= l.x * x4; x58 -= l.y * x5; x58 -= l.z * x6; x58 -= l.w * x7; } { const v4f l = GDN_L4(58, 2); x58 -= l.x * x8; x58 -= l.y * x9; x58 -= l.z * x10; x58 -= l.w * x11; } { const v4f l = GDN_L4(58, 3); x58 -= l.x * x12; x58 -= l.y * x13; x58 -= l.z * x14; x58 -= l.w * x15; } { const v4f l = GDN_L4(58, 4); x58 -= l.x * x16; x58 -= l.y * x17; x58 -= l.z * x18; x58 -= l.w * x19; } { const v4f l = GDN_L4(58, 5); x58 -= l.x * x20; x58 -= l.y * x21; x58 -= l.z * x22; x58 -= l.w * x23; } { const v4f l = GDN_L4(58, 6); x58 -= l.x * x24; x58 -= l.y * x25; x58 -= l.z * x26; x58 -= l.w * x27; } { const v4f l = GDN_L4(58, 7); x58 -= l.x * x28; x58 -= l.y * x29; x58 -= l.z * x30; x58 -= l.w * x31; } { const v4f l = GDN_L4(58, 8); x58 -= l.x * x32; x58 -= l.y * x33; x58 -= l.z * x34; x58 -= l.w * x35; } { const v4f l = GDN_L4(58, 9); x58 -= l.x * x36; x58 -= l.y * x37; x58 -= l.z * x38; x58 -= l.w * x39; } { const v4f l = GDN_L4(58, 10); x58 -= l.x * x40; x58 -= l.y * x41; x58 -= l.z * x42; x58 -= l.w * x43; } { const v4f l = GDN_L4(58, 11); x58 -= l.x * x44; x58 -= l.y * x45; x58 -= l.z * x46; x58 -= l.w * x47; } { const v4f l = GDN_L4(58, 12); x58 -= l.x * x48; x58 -= l.y * x49; x58 -= l.z * x50; x58 -= l.w * x51; } { const v4f l = GDN_L4(58, 13); x58 -= l.x * x52; x58 -= l.y * x53; x58 -= l.z * x54; x58 -= l.w * x55; } { const v4f l = GDN_L4(58, 14); x58 -= l.x * x56; x58 -= l.y * x57; } __builtin_amdgcn_sched_barrier(0);
        float x59 = GDN_RHS(59); { const v4f l = GDN_L4(59, 0); x59 -= l.x * x0; x59 -= l.y * x1; x59 -= l.z * x2; x59 -= l.w * x3; } { const v4f l = GDN_L4(59, 1); x59 -= l.x * x4; x59 -= l.y * x5; x59 -= l.z * x6; x59 -= l.w * x7; } { const v4f l = GDN_L4(59, 2); x59 -= l.x * x8; x59 -= l.y * x9; x59 -= l.z * x10; x59 -= l.w * x11; } { const v4f l = GDN_L4(59, 3); x59 -= l.x * x12; x59 -= l.y * x13; x59 -= l.z * x14; x59 -= l.w * x15; } { const v4f l = GDN_L4(59, 4); x59 -= l.x * x16; x59 -= l.y * x17; x59 -= l.z * x18; x59 -= l.w * x19; } { const v4f l = GDN_L4(59, 5); x59 -= l.x * x20; x59 -= l.y * x21; x59 -= l.z * x22; x59 -= l.w * x23; } { const v4f l = GDN_L4(59, 6); x59 -= l.x * x24; x59 -= l.y * x25; x59 -= l.z * x26; x59 -= l.w * x27; } { const v4f l = GDN_L4(59, 7); x59 -= l.x * x28; x59 -= l.y * x29; x59 -= l.z * x30; x59 -= l.w * x31; } { const v4f l = GDN_L4(59, 8); x59 -= l.x * x32; x59 -= l.y * x33; x59 -= l.z * x34; x59 -= l.w * x35; } { const v4f l = GDN_L4(59, 9); x59 -= l.x * x36; x59 -= l.y * x37; x59 -= l.z * x38; x59 -= l.w * x39; } { const v4f l = GDN_L4(59, 10); x59 -= l.x * x40; x59 -= l.y * x41; x59 -= l.z * x42; x59 -= l.w * x43; } { const v4f l = GDN_L4(59, 11); x59 -= l.x * x44; x59 -= l.y * x45; x59 -= l.z * x46; x59 -= l.w * x47; } { const v4f l = GDN_L4(59, 12); x59 -= l.x * x48; x59 -= l.y * x49; x59 -= l.z * x50; x59 -= l.w * x51; } { const v4f l = GDN_L4(59, 13); x59 -= l.x * x52; x59 -= l.y * x53; x59 -= l.z * x54; x59 -= l.w * x55; } { const v4f l = GDN_L4(59, 14); x59 -= l.x * x56; x59 -= l.y * x57; x59 -= l.z * x58; } __builtin_amdgcn_sched_barrier(0);
        float x60 = GDN_RHS(60); { const v4f l = GDN_L4(60, 0); x60 -= l.x * x0; x60 -= l.y * x1; x60 -= l.z * x2; x60 -= l.w * x3; } { const v4f l = GDN_L4(60, 1); x60 -= l.x * x4; x60 -= l.y * x5; x60 -= l.z * x6; x60 -= l.w * x7; } { const v4f l = GDN_L4(60, 2); x60 -= l.x * x8; x60 -= l.y * x9; x60 -= l.z * x10; x60 -= l.w * x11; } { const v4f l = GDN_L4(60, 3); x60 -= l.x * x12; x60 -= l.y * x13; x60 -= l.z * x14; x60 -= l.w * x15; } { const v4f l = GDN_L4(60, 4); x60 -= l.x * x16; x60 -= l.y * x17; x60 -= l.z * x18; x60 -= l.w * x19; } { const v4f l = GDN_L4(60, 5); x60 -= l.x * x20; x60 -= l.y * x21; x60 -= l.z * x22; x60 -= l.w * x23; } { const v4f l = GDN_L4(60, 6); x60 -= l.x * x24; x60 -= l.y * x25; x60 -= l.z * x26; x60 -= l.w * x27; } { const v4f l = GDN_L4(60, 7); x60 -= l.x * x28; x60 -= l.y * x29; x60 -= l.z * x30; x60 -= l.w * x31; } { const v4f l = GDN_L4(60, 8); x60 -= l.x * x32; x60 -= l.y * x33; x60 -= l.z * x34; x60 -= l.w * x35; } { const v4f l = GDN_L4(60, 9); x60 -= l.x * x36; x60 -= l.y * x37; x60 -= l.z * x38; x60 -= l.w * x39; } { const v4f l = GDN_L4(60, 10); x60 -= l.x * x40; x60 -= l.y * x41; x60 -= l.z * x42; x60 -= l.w * x43; } { const v4f l = GDN_L4(60, 11); x60 -= l.x * x44; x60 -= l.y * x45; x60 -= l.z * x46; x60 -= l.w * x47; } { const v4f l = GDN_L4(60, 12); x60 -= l.x * x48; x60 -= l.y * x49; x60 -= l.z * x50; x60 -= l.w * x51; } { const v4f l = GDN_L4(60, 13); x60 -= l.x * x52; x60 -= l.y * x53; x60 -= l.z * x54; x60 -= l.w * x55; } { const v4f l = GDN_L4(60, 14); x60 -= l.x * x56; x60 -= l.y * x57; x60 -= l.z * x58; x60 -= l.w * x59; } __builtin_amdgcn_sched_barrier(0);
        float x61 = GDN_RHS(61); { const v4f l = GDN_L4(61, 0); x61 -= l.x * x0; x61 -= l.y * x1; x61 -= l.z * x2; x61 -= l.w * x3; } { const v4f l = GDN_L4(61, 1); x61 -= l.x * x4; x61 -= l.y * x5; x61 -= l.z * x6; x61 -= l.w * x7; } { const v4f l = GDN_L4(61, 2); x61 -= l.x * x8; x61 -= l.y * x9; x61 -= l.z * x10; x61 -= l.w * x11; } { const v4f l = GDN_L4(61, 3); x61 -= l.x * x12; x61 -= l.y * x13; x61 -= l.z * x14; x61 -= l.w * x15; } { const v4f l = GDN_L4(61, 4); x61 -= l.x * x16; x61 -= l.y * x17; x61 -= l.z * x18; x61 -= l.w * x19; } { const v4f l = GDN_L4(61, 5); x61 -= l.x * x20; x61 -= l.y * x21; x61 -= l.z * x22; x61 -= l.w * x23; } { const v4f l = GDN_L4(61, 6); x61 -= l.x * x24; x61 -= l.y * x25; x61 -= l.z * x26; x61 -= l.w * x27; } { const v4f l = GDN_L4(61, 7); x61 -= l.x * x28; x61 -= l.y * x29; x61 -= l.z * x30; x61 -= l.w * x31; } { const v4f l = GDN_L4(61, 8); x61 -= l.x * x32; x61 -= l.y * x33; x61 -= l.z * x34; x61 -= l.w * x35; } { const v4f l = GDN_L4(61, 9); x61 -= l.x * x36; x61 -= l.y * x37; x61 -= l.z * x38; x61 -= l.w * x39; } { const v4f l = GDN_L4(61, 10); x61 -= l.x * x40; x61 -= l.y * x41; x61 -= l.z * x42; x61 -= l.w * x43; } { const v4f l = GDN_L4(61, 11); x61 -= l.x * x44; x61 -= l.y * x45; x61 -= l.z * x46; x61 -= l.w * x47; } { const v4f l = GDN_L4(61, 12); x61 -= l.x * x48; x61 -= l.y * x49; x61 -= l.z * x50; x61 -= l.w * x51; } { const v4f l = GDN_L4(61, 13); x61 -= l.x * x52; x61 -= l.y * x53; x61 -= l.z * x54; x61 -= l.w * x55; } { const v4f l = GDN_L4(61, 14); x61 -= l.x * x56; x61 -= l.y * x57; x61 -= l.z * x58; x61 -= l.w * x59; } { const v4f l = GDN_L4(61, 15); x61 -= l.x * x60; } __builtin_amdgcn_sched_barrier(0);
        float x62 = GDN_RHS(62); { const v4f l = GDN_L4(62, 0); x62 -= l.x * x0; x62 -= l.y * x1; x62 -= l.z * x2; x62 -= l.w * x3; } { const v4f l = GDN_L4(62, 1); x62 -= l.x * x4; x62 -= l.y * x5; x62 -= l.z * x6; x62 -= l.w * x7; } { const v4f l = GDN_L4(62, 2); x62 -= l.x * x8; x62 -= l.y * x9; x62 -= l.z * x10; x62 -= l.w * x11; } { const v4f l = GDN_L4(62, 3); x62 -= l.x * x12; x62 -= l.y * x13; x62 -= l.z * x14; x62 -= l.w * x15; } { const v4f l = GDN_L4(62, 4); x62 -= l.x * x16; x62 -= l.y * x17; x62 -= l.z * x18; x62 -= l.w * x19; } { const v4f l = GDN_L4(62, 5); x62 -= l.x * x20; x62 -= l.y * x21; x62 -= l.z * x22; x62 -= l.w * x23; } { const v4f l = GDN_L4(62, 6); x62 -= l.x * x24; x62 -= l.y * x25; x62 -= l.z * x26; x62 -= l.w * x27; } { const v4f l = GDN_L4(62, 7); x62 -= l.x * x28; x62 -= l.y * x29; x62 -= l.z * x30; x62 -= l.w * x31; } { const v4f l = GDN_L4(62, 8); x62 -= l.x * x32; x62 -= l.y * x33; x62 -= l.z * x34; x62 -= l.w * x35; } { const v4f l = GDN_L4(62, 9); x62 -= l.x * x36; x62 -= l.y * x37; x62 -= l.z * x38; x62 -= l.w * x39; } { const v4f l = GDN_L4(62, 10); x62 -= l.x * x40; x62 -= l.y * x41; x62 -= l.z * x42; x62 -= l.w * x43; } { const v4f l = GDN_L4(62, 11); x62 -= l.x * x44; x62 -= l.y * x45; x62 -= l.z * x46; x62 -= l.w * x47; } { const v4f l = GDN_L4(62, 12); x62 -= l.x * x48; x62 -= l.y * x49; x62 -= l.z * x50; x62 -= l.w * x51; } { const v4f l = GDN_L4(62, 13); x62 -= l.x * x52; x62 -= l.y * x53; x62 -= l.z * x54; x62 -= l.w * x55; } { const v4f l = GDN_L4(62, 14); x62 -= l.x * x56; x62 -= l.y * x57; x62 -= l.z * x58; x62 -= l.w * x59; } { const v4f l = GDN_L4(62, 15); x62 -= l.x * x60; x62 -= l.y * x61; } __builtin_amdgcn_sched_barrier(0);
        float x63 = GDN_RHS(63); { const v4f l = GDN_L4(63, 0); x63 -= l.x * x0; x63 -= l.y * x1; x63 -= l.z * x2; x63 -= l.w * x3; } { const v4f l = GDN_L4(63, 1); x63 -= l.x * x4; x63 -= l.y * x5; x63 -= l.z * x6; x63 -= l.w * x7; } { const v4f l = GDN_L4(63, 2); x63 -= l.x * x8; x63 -= l.y * x9; x63 -= l.z * x10; x63 -= l.w * x11; } { const v4f l = GDN_L4(63, 3); x63 -= l.x * x12; x63 -= l.y * x13; x63 -= l.z * x14; x63 -= l.w * x15; } { const v4f l = GDN_L4(63, 4); x63 -= l.x * x16; x63 -= l.y * x17; x63 -= l.z * x18; x63 -= l.w * x19; } { const v4f l = GDN_L4(63, 5); x63 -= l.x * x20; x63 -= l.y * x21; x63 -= l.z * x22; x63 -= l.w * x23; } { const v4f l = GDN_L4(63, 6); x63 -= l.x * x24; x63 -= l.y * x25; x63 -= l.z * x26; x63 -= l.w * x27; } { const v4f l = GDN_L4(63, 7); x63 -= l.x * x28; x63 -= l.y * x29; x63 -= l.z * x30; x63 -= l.w * x31; } { const v4f l = GDN_L4(63, 8); x63 -= l.x * x32; x63 -= l.y * x33; x63 -= l.z * x34; x63 -= l.w * x35; } { const v4f l = GDN_L4(63, 9); x63 -= l.x * x36; x63 -= l.y * x37; x63 -= l.z * x38; x63 -= l.w * x39; } { const v4f l = GDN_L4(63, 10); x63 -= l.x * x40; x63 -= l.y * x41; x63 -= l.z * x42; x63 -= l.w * x43; } { const v4f l = GDN_L4(63, 11); x63 -= l.x * x44; x63 -= l.y * x45; x63 -= l.z * x46; x63 -= l.w * x47; } { const v4f l = GDN_L4(63, 12); x63 -= l.x * x48; x63 -= l.y * x49; x63 -= l.z * x50; x63 -= l.w * x51; } { const v4f l = GDN_L4(63, 13); x63 -= l.x * x52; x63 -= l.y * x53; x63 -= l.z * x54; x63 -= l.w * x55; } { const v4f l = GDN_L4(63, 14); x63 -= l.x * x56; x63 -= l.y * x57; x63 -= l.z * x58; x63 -= l.w * x59; } { const v4f l = GDN_L4(63, 15); x63 -= l.x * x60; x63 -= l.y * x61; x63 -= l.z * x62; } __builtin_amdgcn_sched_barrier(0);
        if (c < 128) { GU[0 * 128 + c] = x0; GU[1 * 128 + c] = x1; GU[2 * 128 + c] = x2; GU[3 * 128 + c] = x3; GU[4 * 128 + c] = x4; GU[5 * 128 + c] = x5; GU[6 * 128 + c] = x6; GU[7 * 128 + c] = x7; GU[8 * 128 + c] = x8; GU[9 * 128 + c] = x9; GU[10 * 128 + c] = x10; GU[11 * 128 + c] = x11; GU[12 * 128 + c] = x12; GU[13 * 128 + c] = x13; GU[14 * 128 + c] = x14; GU[15 * 128 + c] = x15; GU[16 * 128 + c] = x16; GU[17 * 128 + c] = x17; GU[18 * 128 + c] = x18; GU[19 * 128 + c] = x19; GU[20 * 128 + c] = x20; GU[21 * 128 + c] = x21; GU[22 * 128 + c] = x22; GU[23 * 128 + c] = x23; GU[24 * 128 + c] = x24; GU[25 * 128 + c] = x25; GU[26 * 128 + c] = x26; GU[27 * 128 + c] = x27; GU[28 * 128 + c] = x28; GU[29 * 128 + c] = x29; GU[30 * 128 + c] = x30; GU[31 * 128 + c] = x31; GU[32 * 128 + c] = x32; GU[33 * 128 + c] = x33; GU[34 * 128 + c] = x34; GU[35 * 128 + c] = x35; GU[36 * 128 + c] = x36; GU[37 * 128 + c] = x37; GU[38 * 128 + c] = x38; GU[39 * 128 + c] = x39; GU[40 * 128 + c] = x40; GU[41 * 128 + c] = x41; GU[42 * 128 + c] = x42; GU[43 * 128 + c] = x43; GU[44 * 128 + c] = x44; GU[45 * 128 + c] = x45; GU[46 * 128 + c] = x46; GU[47 * 128 + c] = x47; GU[48 * 128 + c] = x48; GU[49 * 128 + c] = x49; GU[50 * 128 + c] = x50; GU[51 * 128 + c] = x51; GU[52 * 128 + c] = x52; GU[53 * 128 + c] = x53; GU[54 * 128 + c] = x54; GU[55 * 128 + c] = x55; GU[56 * 128 + c] = x56; GU[57 * 128 + c] = x57; GU[58 * 128 + c] = x58; GU[59 * 128 + c] = x59; GU[60 * 128 + c] = x60; GU[61 * 128 + c] = x61; GU[62 * 128 + c] = x62; GU[63 * 128 + c] = x63; }
        else { GNW[0 * 128 + (c - 128)] = (bf16)f2bf(-x0); GNW[1 * 128 + (c - 128)] = (bf16)f2bf(-x1); GNW[2 * 128 + (c - 128)] = (bf16)f2bf(-x2); GNW[3 * 128 + (c - 128)] = (bf16)f2bf(-x3); GNW[4 * 128 + (c - 128)] = (bf16)f2bf(-x4); GNW[5 * 128 + (c - 128)] = (bf16)f2bf(-x5); GNW[6 * 128 + (c - 128)] = (bf16)f2bf(-x6); GNW[7 * 128 + (c - 128)] = (bf16)f2bf(-x7); GNW[8 * 128 + (c - 128)] = (bf16)f2bf(-x8); GNW[9 * 128 + (c - 128)] = (bf16)f2bf(-x9); GNW[10 * 128 + (c - 128)] = (bf16)f2bf(-x10); GNW[11 * 128 + (c - 128)] = (bf16)f2bf(-x11); GNW[12 * 128 + (c - 128)] = (bf16)f2bf(-x12); GNW[13 * 128 + (c - 128)] = (bf16)f2bf(-x13); GNW[14 * 128 + (c - 128)] = (bf16)f2bf(-x14); GNW[15 * 128 + (c - 128)] = (bf16)f2bf(-x15); GNW[16 * 128 + (c - 128)] = (bf16)f2bf(-x16); GNW[17 * 128 + (c - 128)] = (bf16)f2bf(-x17); GNW[18 * 128 + (c - 128)] = (bf16)f2bf(-x18); GNW[19 * 128 + (c - 128)] = (bf16)f2bf(-x19); GNW[20 * 128 + (c - 128)] = (bf16)f2bf(-x20); GNW[21 * 128 + (c - 128)] = (bf16)f2bf(-x21); GNW[22 * 128 + (c - 128)] = (bf16)f2bf(-x22); GNW[23 * 128 + (c - 128)] = (bf16)f2bf(-x23); GNW[24 * 128 + (c - 128)] = (bf16)f2bf(-x24); GNW[25 * 128 + (c - 128)] = (bf16)f2bf(-x25); GNW[26 * 128 + (c - 128)] = (bf16)f2bf(-x26); GNW[27 * 128 + (c - 128)] = (bf16)f2bf(-x27); GNW[28 * 128 + (c - 128)] = (bf16)f2bf(-x28); GNW[29 * 128 + (c - 128)] = (bf16)f2bf(-x29); GNW[30 * 128 + (c - 128)] = (bf16)f2bf(-x30); GNW[31 * 128 + (c - 128)] = (bf16)f2bf(-x31); GNW[32 * 128 + (c - 128)] = (bf16)f2bf(-x32); GNW[33 * 128 + (c - 128)] = (bf16)f2bf(-x33); GNW[34 * 128 + (c - 128)] = (bf16)f2bf(-x34); GNW[35 * 128 + (c - 128)] = (bf16)f2bf(-x35); GNW[36 * 128 + (c - 128)] = (bf16)f2bf(-x36); GNW[37 * 128 + (c - 128)] = (bf16)f2bf(-x37); GNW[38 * 128 + (c - 128)] = (bf16)f2bf(-x38); GNW[39 * 128 + (c - 128)] = (bf16)f2bf(-x39); GNW[40 * 128 + (c - 128)] = (bf16)f2bf(-x40); GNW[41 * 128 + (c - 128)] = (bf16)f2bf(-x41); GNW[42 * 128 + (c - 128)] = (bf16)f2bf(-x42); GNW[43 * 128 + (c - 128)] = (bf16)f2bf(-x43); GNW[44 * 128 + (c - 128)] = (bf16)f2bf(-x44); GNW[45 * 128 + (c - 128)] = (bf16)f2bf(-x45); GNW[46 * 128 + (c - 128)] = (bf16)f2bf(-x46); GNW[47 * 128 + (c - 128)] = (bf16)f2bf(-x47); GNW[48 * 128 + (c - 128)] = (bf16)f2bf(-x48); GNW[49 * 128 + (c - 128)] = (bf16)f2bf(-x49); GNW[50 * 128 + (c - 128)] = (bf16)f2bf(-x50); GNW[51 * 128 + (c - 128)] = (bf16)f2bf(-x51); GNW[52 * 128 + (c - 128)] = (bf16)f2bf(-x52); GNW[53 * 128 + (c - 128)] = (bf16)f2bf(-x53); GNW[54 * 128 + (c - 128)] = (bf16)f2bf(-x54); GNW[55 * 128 + (c - 128)] = (bf16)f2bf(-x55); GNW[56 * 128 + (c - 128)] = (bf16)f2bf(-x56); GNW[57 * 128 + (c - 128)] = (bf16)f2bf(-x57); GNW[58 * 128 + (c - 128)] = (bf16)f2bf(-x58); GNW[59 * 128 + (c - 128)] = (bf16)f2bf(-x59); GNW[60 * 128 + (c - 128)] = (bf16)f2bf(-x60); GNW[61 * 128 + (c - 128)] = (bf16)f2bf(-x61); GNW[62 * 128 + (c - 128)] = (bf16)f2bf(-x62); GNW[63 * 128 + (c - 128)] = (bf16)f2bf(-x63); }
#undef GDN_RHS
#undef GDN_L4
    } else {
        const int t2 = tid - 256; const float gl = gcs[63];
        { const int i = t2 >> 2, d0 = (t2 & 3) * 32; const float e = __expf(gcs[i]);
#pragma unroll
          for (int x8 = 0; x8 < 4; ++x8) { const v4f a = *(const LAS v4f*)(qs + i * QP + d0 + 8 * x8), b = *(const LAS v4f*)(qs + i * QP + d0 + 8 * x8 + 4);
              v4u w; w.x = pk2(a.x * e, a.y * e); w.y = pk2(a.z * e, a.w * e); w.z = pk2(b.x * e, b.y * e); w.w = pk2(b.z * e, b.w * e); *(v4u*)(GQG + i * 128 + d0 + 8 * x8) = w; } }
        { const int d = t2 >> 1, j0 = (t2 & 1) * 32;
#pragma unroll
          for (int x8 = 0; x8 < 4; ++x8) { float o[8];
#pragma unroll
              for (int x = 0; x < 8; ++x) { const int j = j0 + 8 * x8 + x; o[x] = ks[j * QP + d] * __expf(gl - gcs[j]); }
              v4u w; w.x = pk2(o[0], o[1]); w.y = pk2(o[2], o[3]); w.z = pk2(o[4], o[5]); w.w = pk2(o[6], o[7]); *(v4u*)(GKT + d * 64 + j0 + 8 * x8) = w; } }
        if (t2 == 0) GDL[item] = __expf(gl);
    }
    __syncthreads();
}
struct GdnFrags { bf16x8_t nw[4], qg[4], at[2], kt[2][2]; float u[4]; float dl; };
__device__ __forceinline__ void gdn_load(GdnFrags& F, const Params& p, int item, int off128, int off64, int offk, int offu) {
    const bf16* GNW = (const bf16*)(p.ws + WS_GNW) + (size_t)item * 8192; const bf16* GQG = (const bf16*)(p.ws + WS_GQG) + (size_t)item * 8192;
    const bf16* GAT = (const bf16*)(p.ws + WS_GAT) + (size_t)item * 4096; const bf16* GKT = (const bf16*)(p.ws + WS_GKT) + (size_t)item * 8192; const float* GU = (const float*)(p.ws + WS_GU) + (size_t)item * 8192;
#pragma unroll
    for (int ks = 0; ks < 4; ++ks) { F.nw[ks] = *(const bf16x8_t*)(GNW + off128 + 32 * ks); F.qg[ks] = *(const bf16x8_t*)(GQG + off128 + 32 * ks); }
#pragma unroll
    for (int ks = 0; ks < 2; ++ks) { F.at[ks] = *(const bf16x8_t*)(GAT + off64 + 32 * ks); F.kt[0][ks] = *(const bf16x8_t*)(GKT + offk + 32 * ks); F.kt[1][ks] = *(const bf16x8_t*)(GKT + offk + 1024 + 32 * ks); }
#pragma unroll
    for (int r = 0; r < 4; ++r) F.u[r] = GU[offu + r * 128];
    F.dl = ((const float*)(p.ws + WS_GDL))[item];
}
constexpr int STP = 136, VNP = 72;
__device__ __forceinline__ void gdn_seq(const Params& p, LAS unsigned char* lds, int wgi, int wave, int lane) {
    const int u = wgi * 2 + (wave >> 2), wi = wave & 3, h = u >> 3, sl = u & 7, g = lane >> 4, c = lane & 15;
    LAS unsigned short* ST = (LAS unsigned short*)(lds + (wave >> 2) * 12288);
    LAS unsigned short* VNT = ST + 2 * 16 * STP;
    float* GO = (float*)(p.ws + WS_GO);
    const int off128 = (16 * wi + c) * 128 + 8 * g, off64 = (16 * wi + c) * 64 + 8 * g, offk = (32 * wi + c) * 64 + 8 * g, offu = (16 * wi + 4 * g) * 128 + 16 * sl + c;
#pragma unroll
    for (int mt = 0; mt < 2; ++mt) *(LAS v2u*)(ST + c * STP + 16 * (2 * wi + mt) + 4 * g) = (v2u){0u, 0u};
    pg8::f32x4 Sacc[2] = {{0.f, 0.f, 0.f, 0.f}, {0.f, 0.f, 0.f, 0.f}};
    __syncthreads();
    GdnFrags F0, F1;
    gdn_load(F0, p, h, off128, off64, offk, offu);
#define GDN_STEP(F, n_) do { const int cur = (n_) & 1; bf16x8_t sf[4]; \
        _Pragma("unroll") for (int ks = 0; ks < 4; ++ks) sf[ks] = *(const LAS bf16x8_t*)(ST + cur * 16 * STP + c * STP + 32 * ks + 8 * g); \
        pg8::f32x4 vn = {F.u[0], F.u[1], F.u[2], F.u[3]}; \
        _Pragma("unroll") for (int ks = 0; ks < 4; ++ks) vn = __builtin_amdgcn_mfma_f32_16x16x32_bf16(F.nw[ks], sf[ks], vn, 0, 0, 0); \
        { v2u w; w.x = pk2(vn[0], vn[1]); w.y = pk2(vn[2], vn[3]); *(LAS v2u*)(VNT + c * VNP + 16 * wi + 4 * g) = w; } \
        LDS_BAR(); \
        const bf16x8_t v0 = *(const LAS bf16x8_t*)(VNT + c * VNP + 8 * g), v1 = *(const LAS bf16x8_t*)(VNT + c * VNP + 32 + 8 * g); \
        pg8::f32x4 o = {0.f, 0.f, 0.f, 0.f}; \
        _Pragma("unroll") for (int ks = 0; ks < 4; ++ks) o = __builtin_amdgcn_mfma_f32_16x16x32_bf16(F.qg[ks], sf[ks], o, 0, 0, 0); \
        o = __builtin_amdgcn_mfma_f32_16x16x32_bf16(F.at[0], v0, o, 0, 0, 0); o = __builtin_amdgcn_mfma_f32_16x16x32_bf16(F.at[1], v1, o, 0, 0, 0); \
        { const size_t tb = (size_t)(n_) * 64 + 16 * wi + 4 * g; _Pragma("unroll") for (int r = 0; r < 4; ++r) GO[(tb + r) * BW + h * 128 + 16 * sl + c] = o[r]; } \
        _Pragma("unroll") for (int mt = 0; mt < 2; ++mt) { Sacc[mt] = Sacc[mt] * F.dl; \
            Sacc[mt] = __builtin_amdgcn_mfma_f32_16x16x32_bf16(F.kt[mt][0], v0, Sacc[mt], 0, 0, 0); Sacc[mt] = __builtin_amdgcn_mfma_f32_16x16x32_bf16(F.kt[mt][1], v1, Sacc[mt], 0, 0, 0); \
            v2u w; w.x = pk2(Sacc[mt][0], Sacc[mt][1]); w.y = pk2(Sacc[mt][2], Sacc[mt][3]); *(LAS v2u*)(ST + (cur ^ 1) * 16 * STP + c * STP + 16 * (2 * wi + mt) + 4 * g) = w; } \
        LDS_BAR(); } while (0)
    for (int n = 0; n < T / 64; n += 2) {
        gdn_load(F1, p, (n + 1) * 4 + h, off128, off64, offk, offu);
        GDN_STEP(F0, n);
        gdn_load(F0, p, ((n + 2 < T / 64) ? n + 2 : n) * 4 + h, off128, off64, offk, offu);
        GDN_STEP(F1, n + 1);
    }
#undef GDN_STEP
}

constexpr int SEQ_UOFF = 132096;
constexpr int GI_NW = 0, GI_QG = 8704, GI_AT = 17408, GI_KT = 22016, GI_SZ = 31232;
struct GdnStage { v4u r[7]; float u[4]; float dl; };
__device__ __forceinline__ void gdn_stage_load(GdnStage& Sg, const Params& p, int item, int tid, int offu) {
    const bf16* GNW = (const bf16*)(p.ws + WS_GNW) + (size_t)item * 8192; const bf16* GQG = (const bf16*)(p.ws + WS_GQG) + (size_t)item * 8192;
    const bf16* GAT = (const bf16*)(p.ws + WS_GAT) + (size_t)item * 4096; const bf16* GKT = (const bf16*)(p.ws + WS_GKT) + (size_t)item * 8192; const float* GU = (const float*)(p.ws + WS_GU) + (size_t)item * 8192;
    Sg.r[0] = *(const v4u*)(GNW + 8 * tid); Sg.r[1] = *(const v4u*)(GNW + 8 * (tid + 512)); Sg.r[2] = *(const v4u*)(GQG + 8 * tid); Sg.r[3] = *(const v4u*)(GQG + 8 * (tid + 512));
    Sg.r[4] = *(const v4u*)(GAT + 8 * tid); Sg.r[5] = *(const v4u*)(GKT + 8 * tid); Sg.r[6] = *(const v4u*)(GKT + 8 * (tid + 512));
#pragma unroll
    for (int r = 0; r < 4; ++r) Sg.u[r] = GU[offu + r * 128];
    Sg.dl = ((const float*)(p.ws + WS_GDL))[item];
}
__device__ __forceinline__ void gdn_stage_write(const GdnStage& Sg, LAS unsigned short* img, int tid) {
    { const int p0 = tid, p1 = tid + 512;
      *(LAS v4u*)(img + GI_NW + (p0 >> 4) * 136 + 8 * (p0 & 15)) = Sg.r[0]; *(LAS v4u*)(img + GI_NW + (p1 >> 4) * 136 + 8 * (p1 & 15)) = Sg.r[1];
      *(LAS v4u*)(img + GI_QG + (p0 >> 4) * 136 + 8 * (p0 & 15)) = Sg.r[2]; *(LAS v4u*)(img + GI_QG + (p1 >> 4) * 136 + 8 * (p1 & 15)) = Sg.r[3];
      *(LAS v4u*)(img + GI_AT + (p0 >> 3) * 72 + 8 * (p0 & 7)) = Sg.r[4];
      *(LAS v4u*)(img + GI_KT + (p0 >> 3) * 72 + 8 * (p0 & 7)) = Sg.r[5]; *(LAS v4u*)(img + GI_KT + (p1 >> 3) * 72 + 8 * (p1 & 7)) = Sg.r[6]; }
}
__device__ __forceinline__ void gdn_seq2(const Params& p, LAS unsigned char* lds, int wgi, int tid, int wave, int lane) {
    const int h = wgi >> 2, sl = 2 * (wgi & 3) + (wave >> 2), wi = wave & 3, g = lane >> 4, c = lane & 15;
    LAS unsigned short* IMG = (LAS unsigned short*)lds;
    LAS unsigned short* ST = (LAS unsigned short*)(lds + SEQ_UOFF + (wave >> 2) * 12288);
    LAS unsigned short* VNT = ST + 2 * 16 * STP;
    float* GO = (float*)(p.ws + WS_GO);
    const int offu = (16 * wi + 4 * g) * 128 + 16 * sl + c;
#pragma unroll
    for (int mt = 0; mt < 2; ++mt) *(LAS v2u*)(ST + c * STP + 16 * (2 * wi + mt) + 4 * g) = (v2u){0u, 0u};
    pg8::f32x4 Sacc[2] = {{0.f, 0.f, 0.f, 0.f}, {0.f, 0.f, 0.f, 0.f}};
    GdnStage A, B;
    gdn_stage_load(A, p, h, tid, offu); gdn_stage_write(A, IMG, tid);
    gdn_stage_load(B, p, 4 + h, tid, offu);
    LDS_BAR();
    constexpr int NCH = T / 64;
#define GDN_STEP2(X, Y, n_) do { const int cur = (n_) & 1; const LAS unsigned short* im = IMG + cur * GI_SZ; bf16x8_t sf[4]; \
        _Pragma("unroll") for (int ks = 0; ks < 4; ++ks) sf[ks] = *(const LAS bf16x8_t*)(ST + cur * 16 * STP + c * STP + 32 * ks + 8 * g); \
        pg8::f32x4 vn = {X.u[0], X.u[1], X.u[2], X.u[3]}; const float dl = X.dl; \
        _Pragma("unroll") for (int ks = 0; ks < 4; ++ks) vn = __builtin_amdgcn_mfma_f32_16x16x32_bf16(*(const LAS bf16x8_t*)(im + GI_NW + (16 * wi + c) * 136 + 32 * ks + 8 * g), sf[ks], vn, 0, 0, 0); \
        { v2u w; w.x = pk2(vn[0], vn[1]); w.y = pk2(vn[2], vn[3]); *(LAS v2u*)(VNT + c * VNP + 16 * wi + 4 * g) = w; } \
        pg8::f32x4 o = {0.f, 0.f, 0.f, 0.f}; \
        _Pragma("unroll") for (int ks = 0; ks < 4; ++ks) o = __builtin_amdgcn_mfma_f32_16x16x32_bf16(*(const LAS bf16x8_t*)(im + GI_QG + (16 * wi + c) * 136 + 32 * ks + 8 * g), sf[ks], o, 0, 0, 0); \
        LDS_BAR(); \
        gdn_stage_load(X, p, (((n_) + 2 < NCH) ? (n_) + 2 : (n_)) * 4 + h, tid, offu); \
        const bf16x8_t v0 = *(const LAS bf16x8_t*)(VNT + c * VNP + 8 * g), v1 = *(const LAS bf16x8_t*)(VNT + c * VNP + 32 + 8 * g); \
        o = __builtin_amdgcn_mfma_f32_16x16x32_bf16(*(const LAS bf16x8_t*)(im + GI_AT + (16 * wi + c) * 72 + 8 * g), v0, o, 0, 0, 0); \
        o = __builtin_amdgcn_mfma_f32_16x16x32_bf16(*(const LAS bf16x8_t*)(im + GI_AT + (16 * wi + c) * 72 + 32 + 8 * g), v1, o, 0, 0, 0); \
        { const size_t tb = (size_t)(n_) * 64 + 16 * wi + 4 * g; _Pragma("unroll") for (int r = 0; r < 4; ++r) GO[(tb + r) * BW + h * 128 + 16 * sl + c] = o[r]; } \
        _Pragma("unroll") for (int mt = 0; mt < 2; ++mt) { Sacc[mt] = Sacc[mt] * dl; \
            Sacc[mt] = __builtin_amdgcn_mfma_f32_16x16x32_bf16(*(const LAS bf16x8_t*)(im + GI_KT + (16 * (2 * wi + mt) + c) * 72 + 8 * g), v0, Sacc[mt], 0, 0, 0); \
            Sacc[mt] = __builtin_amdgcn_mfma_f32_16x16x32_bf16(*(const LAS bf16x8_t*)(im + GI_KT + (16 * (2 * wi + mt) + c) * 72 + 32 + 8 * g), v1, Sacc[mt], 0, 0, 0); \
            v2u w; w.x = pk2(Sacc[mt][0], Sacc[mt][1]); w.y = pk2(Sacc[mt][2], Sacc[mt][3]); *(LAS v2u*)(ST + (cur ^ 1) * 16 * STP + c * STP + 16 * (2 * wi + mt) + 4 * g) = w; } \
        gdn_stage_write(Y, IMG + (cur ^ 1) * GI_SZ, tid); \
        LDS_BAR(); } while (0)
    for (int n = 0; n < NCH; n += 2) { GDN_STEP2(A, B, n); GDN_STEP2(B, A, n + 1); }
#undef GDN_STEP2
}
constexpr int MI_Q = 0, MI_S = 4608, MI_K = 9216, MI_SZ = 13824;
struct MlStage { v4u r[3]; bf16x8_t vt[2]; float fl; };
__device__ __forceinline__ void ml_stage_load(MlStage& Sg, const Params& p, int item, int tid, int offV) {
    const bf16* MQ = (const bf16*)(p.ws + WS_MQ) + (size_t)item * 4096; const bf16* MS = (const bf16*)(p.ws + WS_MS) + (size_t)item * 4096; const bf16* MK = (const bf16*)(p.ws + WS_MK) + (size_t)item * 4096;
    const bf16* MV = (const bf16*)(p.ws + WS_MV) + (size_t)item * 9216;
    Sg.r[0] = *(const v4u*)(MQ + 8 * tid); Sg.r[1] = *(const v4u*)(MS + 8 * tid); Sg.r[2] = *(const v4u*)(MK + 8 * tid);
    Sg.vt[0] = *(const bf16x8_t*)(MV + offV); Sg.vt[1] = *(const bf16x8_t*)(MV + offV + 32);
    Sg.fl = ((const float*)(p.ws + WS_MFL))[item];
}
__device__ __forceinline__ void ml_stage_write(const MlStage& Sg, LAS unsigned short* img, int tid) {
    const int o = (tid >> 3) * 72 + 8 * (tid & 7);
    *(LAS v4u*)(img + MI_Q + o) = Sg.r[0]; *(LAS v4u*)(img + MI_S + o) = Sg.r[1]; *(LAS v4u*)(img + MI_K + o) = Sg.r[2];
}
__device__ __forceinline__ void ml_seq2(const Params& p, LAS unsigned char* lds, int wgi, int tid, int wave, int lane) {
    const int h = wgi / 5, sl0 = 2 * (wgi % 5) + (wave >> 2), wi = wave & 3, g = lane >> 4, c = lane & 15;
    const bool real = sl0 < 9; const int sl = real ? sl0 : 8;
    LAS unsigned short* IMG = (LAS unsigned short*)lds;
    LAS unsigned short* CT = (LAS unsigned short*)(lds + SEQ_UOFF + (wave >> 2) * 8192);
    float* HO = (float*)(p.ws + WS_HO); float* HDEN = (float*)(p.ws + WS_HDEN);
    const int offV = (16 * sl + c) * 64 + 8 * g;
    *(LAS v2u*)(CT + c * 72 + 16 * wi + 4 * g) = (v2u){0u, 0u};
    pg8::f32x4 Cacc = {0.f, 0.f, 0.f, 0.f};
    MlStage A, B;
    ml_stage_load(A, p, h, tid, offV); ml_stage_write(A, IMG, tid);
    ml_stage_load(B, p, 4 + h, tid, offV);
    LDS_BAR();
    constexpr int NCH = T / 64;
#define ML_STEP2(X, Y, n_) do { const int cur = (n_) & 1; const LAS unsigned short* im = IMG + cur * MI_SZ; const int ro = (16 * wi + c) * 72 + 8 * g; \
        const bf16x8_t c0 = *(const LAS bf16x8_t*)(CT + cur * 16 * 72 + c * 72 + 8 * g), c1 = *(const LAS bf16x8_t*)(CT + cur * 16 * 72 + c * 72 + 32 + 8 * g); \
        const bf16x8_t vt0 = X.vt[0], vt1 = X.vt[1]; const float fl = X.fl; \
        pg8::f32x4 num = {0.f, 0.f, 0.f, 0.f}; \
        num = __builtin_amdgcn_mfma_f32_16x16x32_bf16(*(const LAS bf16x8_t*)(im + MI_Q + ro), c0, num, 0, 0, 0); num = __builtin_amdgcn_mfma_f32_16x16x32_bf16(*(const LAS bf16x8_t*)(im + MI_Q + ro + 32), c1, num, 0, 0, 0); \
        num = __builtin_amdgcn_mfma_f32_16x16x32_bf16(*(const LAS bf16x8_t*)(im + MI_S + ro), vt0, num, 0, 0, 0); num = __builtin_amdgcn_mfma_f32_16x16x32_bf16(*(const LAS bf16x8_t*)(im + MI_S + ro + 32), vt1, num, 0, 0, 0); \
        Cacc = Cacc * fl; \
        Cacc = __builtin_amdgcn_mfma_f32_16x16x32_bf16(*(const LAS bf16x8_t*)(im + MI_K + ro), vt0, Cacc, 0, 0, 0); Cacc = __builtin_amdgcn_mfma_f32_16x16x32_bf16(*(const LAS bf16x8_t*)(im + MI_K + ro + 32), vt1, Cacc, 0, 0, 0); \
        ml_stage_load(X, p, (((n_) + 2 < NCH) ? (n_) + 2 : (n_)) * 4 + h, tid, offV); \
        { v2u w; w.x = pk2(Cacc[0], Cacc[1]); w.y = pk2(Cacc[2], Cacc[3]); *(LAS v2u*)(CT + (cur ^ 1) * 16 * 72 + c * 72 + 16 * wi + 4 * g) = w; } \
        { const size_t tb = (size_t)(n_) * 64 + 16 * wi + 4 * g; \
          if (sl < 8) { _Pragma("unroll") for (int r = 0; r < 4; ++r) HO[(tb + r) * BW + h * 128 + 16 * sl + c] = num[r]; } \
          else if (c == 0 && real) { _Pragma("unroll") for (int r = 0; r < 4; ++r) HDEN[(tb + r) * 4 + h] = num[r]; } } \
        ml_stage_write(Y, IMG + (cur ^ 1) * MI_SZ, tid); \
        LDS_BAR(); } while (0)
    for (int n = 0; n < NCH; n += 2) { ML_STEP2(A, B, n); ML_STEP2(B, A, n + 1); }
#undef ML_STEP2
}

__device__ __forceinline__ void mixer_gmlp_item(const Params& p, int l, LAS unsigned char* lds, int item, int tid, int wave, int lane) {
    const int chunk = item >> 2, g = item & 3; const size_t tok0 = (size_t)chunk * 128;
    const bf16* Z = (const bf16*)(p.ws + WS_Z); bf16* BR1 = (bf16*)(p.ws + WS_BR) + 1 * BW;
    const float* ng = p.in[I_GMNG] + l * BW; const float* nb = p.in[I_GMNB] + l * BW;
    const float* wsp = p.in[I_GMWS] + ((size_t)(l * 4 + g) * 128) * 128; const float* bsp = p.in[I_GMBS] + (l * 4 + g) * 128;
    LAS float* vn = (LAS float*)lds;
    for (int r = 0; r < 16; ++r) { const int tk = wave * 16 + r;
        const v4u raw = *(const v4u*)(Z + (tok0 + tk) * ZC + ZC_GMV + 8 * lane); float x[8]; unpack8(raw, x); float s = 0.f;
#pragma unroll
        for (int i = 0; i < 8; ++i) { x[i] = gelu_tanh(x[i]); s += x[i]; }
        const float mean = wave_sum(s) * (1.f / 512.f); float ss = 0.f;
#pragma unroll
        for (int i = 0; i < 8; ++i) { x[i] -= mean; ss += x[i] * x[i]; }
        const float rstd = rsqrtf(wave_sum(ss) * (1.f / 512.f) + LN_EPS);
        if ((lane >> 4) == g) { const int cl = 8 * (lane & 15);
#pragma unroll
            for (int i = 0; i < 8; ++i) vn[tk * 128 + cl + i] = x[i] * rstd * ng[8 * lane + i] + nb[8 * lane + i]; }
    }
    __syncthreads();
    const int t = tid >> 2, cq = tid & 3; float acc[32];
#pragma unroll
    for (int i = 0; i < 32; ++i) acc[i] = 0.f;
    const float* wrow = wsp + (size_t)t * 128;
    for (int s = 0; s <= t; ++s) { const float w = wrow[s]; const LAS float* row = vn + s * 128 + cq * 32;
#pragma unroll
        for (int i4 = 0; i4 < 8; ++i4) { const v4f a = *(const LAS v4f*)(row + 4 * i4); acc[4 * i4] += w * a.x; acc[4 * i4 + 1] += w * a.y; acc[4 * i4 + 2] += w * a.z; acc[4 * i4 + 3] += w * a.w; } }
    const float bias = bsp[t];
#pragma unroll
    for (int i8 = 0; i8 < 4; ++i8) { const v4u raw = *(const v4u*)(Z + (tok0 + t) * ZC + ZC_GMU + g * 128 + cq * 32 + 8 * i8); float u[8]; unpack8(raw, u); float o[8];
#pragma unroll
        for (int i = 0; i < 8; ++i) o[i] = gelu_tanh(u[i]) * (acc[8 * i8 + i] + bias);
        v4u w; w.x = pk2(o[0], o[1]); w.y = pk2(o[2], o[3]); w.z = pk2(o[4], o[5]); w.w = pk2(o[6], o[7]);
        *(v4u*)(BR1 + (tok0 + t) * BRW + g * 128 + cq * 32 + 8 * i8) = w; }
    __syncthreads();
}

__device__ __forceinline__ void vt_item(const Params& p, LAS unsigned char* lds, int item, int tid) {
    const int h = item & 3, n = item >> 2; const size_t t0 = (size_t)n * 64;
    const bf16* Z = (const bf16*)(p.ws + WS_Z); bf16* VT = (bf16*)(p.ws + WS_VT);
    LAS unsigned short* vs = (LAS unsigned short*)lds;
#pragma unroll
    for (int r = 0; r < 2; ++r) { const int idx = tid + 512 * r, tk = idx >> 4, c8 = idx & 15;
        *(LAS v4u*)(vs + tk * 136 + 8 * c8) = *(const v4u*)(Z + (t0 + tk) * ZC + ZC_SBV + h * 128 + 8 * c8); }
    __syncthreads();
    { const int d = tid >> 2, jq = tid & 3; unsigned w[8];
#pragma unroll
      for (int x = 0; x < 8; ++x) w[x] = (unsigned)vs[(16 * jq + 2 * x) * 136 + d] | ((unsigned)vs[(16 * jq + 2 * x + 1) * 136 + d] << 16);
      bf16* dst = VT + ((size_t)h * 128 + d) * T + t0 + 16 * jq;
      *(v4u*)dst = (v4u){w[0], w[1], w[2], w[3]}; *(v4u*)(dst + 8) = (v4u){w[4], w[5], w[6], w[7]}; }
    __syncthreads();
}
constexpr int KTP = 136, VTP = 72;
__device__ __forceinline__ void sb_unit(const Params& p, LAS unsigned char* lds, int unit, int tid, int wave, int lane) {
    const int h = unit >> 6, q0 = (unit & 63) * 128, g = lane >> 4, c = lane & 15; const int qrow = q0 + 16 * wave + c;
    const bf16* Z = (const bf16*)(p.ws + WS_Z); const bf16* VT = (const bf16*)(p.ws + WS_VT) + (size_t)h * 128 * T; bf16* BR0 = (bf16*)(p.ws + WS_BR);
    LAS unsigned short* Kt = (LAS unsigned short*)lds;
    LAS unsigned short* Vt = Kt + 2 * 64 * KTP;
    LAS int* flags = (LAS int*)(Vt + 2 * 128 * VTP);
    bf16x8_t qf[4];
#pragma unroll
    for (int ks = 0; ks < 4; ++ks) qf[ks] = *(const bf16x8_t*)(Z + (size_t)qrow * ZC + ZC_SBQ + h * 128 + 32 * ks + 8 * g);
    pg8::f32x4 acc[8];
#pragma unroll
    for (int dt = 0; dt < 8; ++dt) acc[dt] = (pg8::f32x4){0.f, 0.f, 0.f, 0.f};
    float racc = 0.f;
    v4u kr[2], vr[2];
    const int jt = (q0 >> 6) + 1;
#define SB_GLOAD(j_) do { _Pragma("unroll") for (int r = 0; r < 2; ++r) { const int idx = tid + 512 * r; \
        kr[r] = *(const v4u*)(Z + (size_t)(64 * (j_) + (idx >> 4)) * ZC + ZC_SBK + h * 128 + 8 * (idx & 15)); \
        vr[r] = *(const v4u*)(VT + (size_t)(idx >> 3) * T + 64 * (j_) + 8 * (idx & 7)); } } while (0)
#define SB_LWRITE(b_) do { _Pragma("unroll") for (int r = 0; r < 2; ++r) { const int idx = tid + 512 * r; \
        *(LAS v4u*)(Kt + (b_) * 64 * KTP + (idx >> 4) * KTP + 8 * (idx & 15)) = kr[r]; *(LAS v4u*)(Vt + (b_) * 128 * VTP + (idx >> 3) * VTP + 8 * (idx & 7)) = vr[r]; } } while (0)
    LDS_BAR();
    SB_GLOAD(jt); SB_LWRITE(0);
    LDS_BAR();
    for (int j = jt, it = 0; j >= 0; --j, ++it) {
        const int cur = it & 1;
        SB_GLOAD(j > 0 ? j - 1 : 0);
        const bool wdone = __all(racc > 104.f);
        if (64 * j < q0 + 16 * wave + 15 && !wdone) {
            const LAS unsigned short* Kc = Kt + cur * 64 * KTP; const LAS unsigned short* Vc = Vt + cur * 128 * VTP;
            pg8::f32x4 z[4];
#pragma unroll
            for (int s = 0; s < 4; ++s) { z[s] = (pg8::f32x4){0.f, 0.f, 0.f, 0.f};
#pragma unroll
                for (int ks = 0; ks < 4; ++ks) z[s] = __builtin_amdgcn_mfma_f32_16x16x32_bf16(*(const LAS bf16x8_t*)(Kc + (16 * s + c) * KTP + 32 * ks + 8 * g), qf[ks], z[s], 0, 0, 0); }
            float sp[4][4], t[4], xs[4]; bool mk[4][4];
#pragma unroll
            for (int s = 0; s < 4; ++s) { t[s] = 0.f;
#pragma unroll
                for (int r = 0; r < 4; ++r) { const int key = 64 * j + 16 * s + 4 * g + r; mk[s][r] = key < qrow; const float zz = z[s][r] * 0.08838834764831845f; z[s][r] = zz;
                    sp[s][r] = mk[s][r] ? softplusf_(zz) : 0.f; t[s] += sp[s][r]; } }
            float grand = 0.f, higher[4];
#pragma unroll
            for (int s = 3; s >= 0; --s) { float x = t[s]; float y = __shfl(x, lane + 16); x += (g < 3) ? y : 0.f; y = __shfl(x, lane + 32); x += (g < 2) ? y : 0.f;
                xs[s] = x - t[s];
                const float tot = __shfl(x, c); higher[s] = grand; grand += tot; }
            bf16x8_t pf[2];
#pragma unroll
            for (int s = 0; s < 4; ++s) { float a[4]; float e = 0.f;
#pragma unroll
                for (int r = 3; r >= 0; --r) { const float la = z[s][r] - sp[s][r] - (racc + higher[s] + xs[s] + e); a[r] = mk[s][r] ? __expf(la) : 0.f; e += sp[s][r]; }
                const unsigned w0 = pk2(a[0], a[1]), w1 = pk2(a[2], a[3]);
                if ((s & 1) == 0) { pf[s >> 1][0] = (short)(w0 & 0xffff); pf[s >> 1][1] = (short)(w0 >> 16); pf[s >> 1][2] = (short)(w1 & 0xffff); pf[s >> 1][3] = (short)(w1 >> 16); }
                else              { pf[s >> 1][4] = (short)(w0 & 0xffff); pf[s >> 1][5] = (short)(w0 >> 16); pf[s >> 1][6] = (short)(w1 & 0xffff); pf[s >> 1][7] = (short)(w1 >> 16); } }
            racc += grand;
#pragma unroll
            for (int dt = 0; dt < 8; ++dt)
#pragma unroll
                for (int k2 = 0; k2 < 2; ++k2) { const v2u lo = *(const LAS v2u*)(Vc + (16 * dt + c) * VTP + 32 * k2 + 4 * g), hi = *(const LAS v2u*)(Vc + (16 * dt + c) * VTP + 32 * k2 + 16 + 4 * g);
                    const v4u vv = (v4u){lo.x, lo.y, hi.x, hi.y};
                    acc[dt] = __builtin_amdgcn_mfma_f32_16x16x32_bf16(__builtin_bit_cast(bf16x8_t, vv), pf[k2], acc[dt], 0, 0, 0); }
        }
        const bool wd2 = __all(racc > 104.f);
        if (lane == 0) flags[cur * 8 + wave] = wd2 ? 1 : 0;
        SB_LWRITE(cur ^ 1);
        LDS_BAR();
        int alld = 1;
#pragma unroll
        for (int w = 0; w < 8; ++w) alld &= flags[cur * 8 + w];
        if (alld) break;
    }
#undef SB_GLOAD
#undef SB_LWRITE
#pragma unroll
    for (int dt = 0; dt < 8; ++dt) { v2u w; w.x = pk2(acc[dt][0], acc[dt][1]); w.y = pk2(acc[dt][2], acc[dt][3]); *(v2u*)(BR0 + (size_t)qrow * BRW + h * 128 + 16 * dt + 4 * g) = w; }
}

__device__ __forceinline__ void phase_mixers(const Params& p, int l, LAS unsigned char* lds, int wg, int G, int tid, int wave, int lane, const XcdBarrier& bar) {
#if defined(PROBE_SPLIT)
    if (wg < 16) gdn_seq2(p, lds, wg, tid, wave, lane); else if (wg < 36) ml_seq2(p, lds, wg - 16, tid, wave, lane);
    xcd_barrier(bar);
    const int w2 = wg, G2 = G;
#else
    if (wg < 16) { gdn_seq2(p, lds, wg, tid, wave, lane); return; }
    if (wg < 36) { ml_seq2(p, lds, wg - 16, tid, wave, lane); return; }
    const int w2 = wg - 36, G2 = G - 36;
#endif
    for (int it = w2; it < 256; it += G2) mixer_gmlp_item(p, l, lds, it, tid, wave, lane);
    for (int it = w2; it < 256; it += G2) sb_unit(p, lds, it, tid, wave, lane);
#if !defined(PROBE_CONV0)
    __syncthreads();
#if defined(PROBE_CONVDUP)
#pragma nounroll
    for (int rep = 0; rep < 2; ++rep)
#endif
    phase_convert<1>(p, l, lds, w2 * 8 + wave, G2 * 8, wave, lane
#if defined(PROBE_CONVDUP)
        , (PROBE_CONVDUP == 2) && rep == 1
#endif
        );
#endif
}

__device__ __forceinline__ void phase_post(const Params& p, int l, int gw, int NGW, int lane) {
    const bf16* Z = (const bf16*)(p.ws + WS_Z); const float* GO = (const float*)(p.ws + WS_GO); const float* HO = (const float*)(p.ws + WS_HO); const float* HDEN = (const float*)(p.ws + WS_HDEN);
    bf16* BR2 = (bf16*)(p.ws + WS_BR) + 2 * BW; bf16* BR3 = (bf16*)(p.ws + WS_BR) + 3 * BW;
    const float* gng = p.in[I_GDNNG] + l * 128; const float* mng = p.in[I_MLNG] + l * BW;
    for (int t = gw; t < T; t += NGW) {
        {   const v4f a0 = *(const v4f*)(GO + (size_t)t * BW + 8 * lane), a1 = *(const v4f*)(GO + (size_t)t * BW + 8 * lane + 4); float o[8] = {a0.x, a0.y, a0.z, a0.w, a1.x, a1.y, a1.z, a1.w}; float ss = 0.f;
#pragma unroll
            for (int i = 0; i < 8; ++i) ss += o[i] * o[i];
            const float r = rsqrtf(sum16(ss) * (1.f / 128.f) + LN_EPS);
            const v4u graw = *(const v4u*)(Z + (size_t)t * ZC + ZC_GDNG + 8 * lane); float gt[8]; unpack8(graw, gt);
#pragma unroll
            for (int i = 0; i < 8; ++i) o[i] = o[i] * r * gng[(8 * lane + i) & 127] * siluf_(gt[i]);
            v4u w; w.x = pk2(o[0], o[1]); w.y = pk2(o[2], o[3]); w.z = pk2(o[4], o[5]); w.w = pk2(o[6], o[7]); *(v4u*)(BR2 + (size_t)t * BRW + 8 * lane) = w; }
        {   const v4f a0 = *(const v4f*)(HO + (size_t)t * BW + 8 * lane), a1 = *(const v4f*)(HO + (size_t)t * BW + 8 * lane + 4); float o[8] = {a0.x, a0.y, a0.z, a0.w, a1.x, a1.y, a1.z, a1.w}; float ss = 0.f;
            const float dn = 1.f / fmaxf(fabsf(HDEN[(size_t)t * 4 + (lane >> 4)]), 1.f);
#pragma unroll
            for (int i = 0; i < 8; ++i) { o[i] *= dn; ss += o[i] * o[i]; }
            const float r = rsqrtf(sum16(ss) * (1.f / 128.f) + LN_EPS);
            const v4u graw = *(const v4u*)(Z + (size_t)t * ZC + ZC_MLO + 8 * lane); float gt[8]; unpack8(graw, gt);
#pragma unroll
            for (int i = 0; i < 8; ++i) o[i] = o[i] * r * mng[8 * lane + i] * sigmoidf_(gt[i]);
            v4u w; w.x = pk2(o[0], o[1]); w.y = pk2(o[2], o[3]); w.z = pk2(o[4], o[5]); w.w = pk2(o[6], o[7]); *(v4u*)(BR3 + (size_t)t * BRW + 8 * lane) = w; }
    }
}

__device__ __forceinline__ void ln_row(const float* yrow, const float* g, const float* b, int lane, v4f (&v)[8]) {
    const v4f* yr = (const v4f*)yrow + lane; float s = 0.f;
#pragma unroll
    for (int j = 0; j < 8; ++j) { v[j] = yr[64 * j]; s += (v[j].x + v[j].y) + (v[j].z + v[j].w); }
    const float mean = wave_sum(s) * (1.f / D); float s2 = 0.f;
#pragma unroll
    for (int j = 0; j < 8; ++j) { v[j] = v[j] - mean; s2 += (v[j].x * v[j].x + v[j].y * v[j].y) + (v[j].z * v[j].z + v[j].w * v[j].w); }
    const float rstd = rsqrtf(wave_sum(s2) * (1.f / D) + LN_EPS);
#pragma unroll
    for (int j = 0; j < 8; ++j) { const v4f gg = ((const v4f*)g)[lane + 64 * j], bb = ((const v4f*)b)[lane + 64 * j]; v[j] = v[j] * rstd * gg + bb; }
}
constexpr int RT_XP = 2052;
constexpr int RT_TAB = 131072 + 1024;
__device__ __forceinline__ void phase_ln1_router(const Params& p, int l, LAS unsigned char* lds, int wg, int G, int wave, int lane, int cnt_shift = 0) {
    const float* Y = (const float*)(p.ws + WS_Y); float* X1 = (float*)(p.ws + WS_X1); bf16* X1B = (bf16*)(p.ws + WS_X1B); int* LIST = (int*)(p.ws + WS_LIST); float* WL = (float*)(p.ws + WS_WL); unsigned* SLOT = (unsigned*)(p.ws + WS_SLOT);
    unsigned* cnt = (unsigned*)(p.ws + WS_CTL) + CW_CNT + l * 4096 + cnt_shift;
    const float* g1 = p.in[I_LN1G] + (size_t)l * D; const float* b1 = p.in[I_LN1B] + (size_t)l * D;
    const float* wr = p.in[I_WR] + (size_t)l * D * NE; const float rbias = p.in[I_RB][l * NE + lane];
    LAS float* xt = (LAS float*)lds;
    LAS float* part = (LAS float*)lds;
    LAS unsigned char* selm = lds + RT_TAB; LAS unsigned char* rkm = selm + 4096; LAS float* wtm = (LAS float*)(rkm + 4096); LAS unsigned* basem = (LAS unsigned*)(wtm + 4096);
    const int n_l = lane & 15, kq = lane >> 4;
    int gi = 0;
    for (int tg = wg; tg < T / 16; tg += G, ++gi) {
        {   v4f va[8], vb[8]; const size_t m0 = (size_t)tg * 16 + 2 * wave;
            const v4f* ya = (const v4f*)(Y + m0 * D) + lane; const v4f* yb = (const v4f*)(Y + (m0 + 1) * D) + lane;
#pragma unroll
            for (int j = 0; j < 8; ++j) { va[j] = ya[64 * j]; vb[j] = yb[64 * j]; }
            float sa = 0.f, sb = 0.f;
#pragma unroll
            for (int j = 0; j < 8; ++j) { sa += (va[j].x + va[j].y) + (va[j].z + va[j].w); sb += (vb[j].x + vb[j].y) + (vb[j].z + vb[j].w); }
            const float ma = wave_sum(sa) * (1.f / D), mb = wave_sum(sb) * (1.f / D); float qa = 0.f, qb = 0.f;
#pragma unroll
            for (int j = 0; j < 8; ++j) { va[j] = va[j] - ma; vb[j] = vb[j] - mb; qa += (va[j].x * va[j].x + va[j].y * va[j].y) + (va[j].z * va[j].z + va[j].w * va[j].w); qb += (vb[j].x * vb[j].x + vb[j].y * vb[j].y) + (vb[j].z * vb[j].z + vb[j].w * vb[j].w); }
            const float ra = rsqrtf(wave_sum(qa) * (1.f / D) + LN_EPS), rb = rsqrtf(wave_sum(qb) * (1.f / D) + LN_EPS);
#pragma unroll
            for (int j = 0; j < 8; ++j) { const v4f gg = ((const v4f*)g1)[lane + 64 * j], bb = ((const v4f*)b1)[lane + 64 * j]; va[j] = va[j] * ra * gg + bb; vb[j] = vb[j] * rb * gg + bb; }
#pragma unroll
            for (int rr = 0; rr < 2; ++rr) { const size_t m = m0 + rr; v4f* xo = (v4f*)(X1 + m * D) + lane;
#pragma unroll
                for (int j = 0; j < 8; ++j) { const v4f v = rr ? vb[j] : va[j]; xo[64 * j] = v;
#if MOE_UP_FP8
                    { unsigned w = 0; w = __builtin_amdgcn_cvt_pk_fp8_f32(v.x, v.y, w, false); w = __builtin_amdgcn_cvt_pk_fp8_f32(v.z, v.w, w, true); ((unsigned*)((unsigned char*)X1B + m * D))[lane + 64 * j] = w; }
#else
                    { v2u o; o.x = pk2(v.x, v.y); o.y = pk2(v.z, v.w); ((v2u*)(X1B + m * D))[lane + 64 * j] = o; }
#endif
                    *(LAS v4f*)(xt + (2 * wave + rr) * RT_XP + 4 * lane + 256 * j) = v; } } }
        __syncthreads();
        {   pg8::f32x4 acc[4];
#pragma unroll
            for (int i = 0; i < 4; ++i) acc[i] = (pg8::f32x4){0.f, 0.f, 0.f, 0.f};
            const float* wb = wr + (size_t)(256 * wave + 4 * kq) * NE + 4 * n_l;
            const LAS float* xa = xt + n_l * RT_XP + 256 * wave + 4 * kq;
            v4f bwa[16], bwb[16];
#define RT_LOADW(dst, sb_) do { _Pragma("unroll") for (int q = 0; q < 16; ++q) dst[q] = *(const v4f*)(wb + (size_t)(16 * (4 * (sb_) + (q >> 2)) + (q & 3)) * NE); } while (0)
#define RT_MMA(src, sb_) do { _Pragma("unroll") for (int sg = 0; sg < 4; ++sg) { const v4f a4 = *(const LAS v4f*)(xa + 16 * (4 * (sb_) + sg)); \
                _Pragma("unroll") for (int c = 0; c < 4; ++c) { const v4f b4 = src[sg * 4 + c]; const float a = c == 0 ? a4.x : c == 1 ? a4.y : c == 2 ? a4.z : a4.w; \
                    acc[0] = __builtin_amdgcn_mfma_f32_16x16x4f32(a, b4.x, acc[0], 0, 0, 0); acc[1] = __builtin_amdgcn_mfma_f32_16x16x4f32(a, b4.y, acc[1], 0, 0, 0); \
                    acc[2] = __builtin_amdgcn_mfma_f32_16x16x4f32(a, b4.z, acc[2], 0, 0, 0); acc[3] = __builtin_amdgcn_mfma_f32_16x16x4f32(a, b4.w, acc[3], 0, 0, 0); } } } while (0)
            RT_LOADW(bwa, 0);
#pragma unroll 1
            for (int h = 0; h < 2; ++h) {
                RT_LOADW(bwb, 1); RT_MMA(bwa, 0);
                if (h == 0) RT_LOADW(bwa, 2);
                RT_MMA(bwb, 1);
                wb += (size_t)128 * NE; xa += 128; asm volatile("" : "+v"(wb));
            }
#undef RT_LOADW
#undef RT_MMA
            __syncthreads();
#pragma unroll
            for (int j = 0; j < 4; ++j) *(LAS v4f*)(part + (wave * 16 + 4 * kq + j) * 64 + 4 * n_l) = (v4f){acc[0][j], acc[1][j], acc[2][j], acc[3][j]}; }
        __syncthreads();
#pragma unroll 1
        for (int rr = 0; rr < 2; ++rr) { const int lr = wave + 8 * rr; float logit = 0.f;
#pragma unroll
            for (int w = 0; w < 8; ++w) logit += part[(w * 16 + lr) * 64 + lane];
            const float s = sigmoidf_(logit), biased = s + rbias;
            const float m1 = max8(biased); const float li = (float)(lane & 7);
            const float first = min8(biased == m1 ? li : 8.f);
            const float m2 = max8(li == first ? -INFINITY : biased);
            const float gs = m1 + m2; const int myg = lane >> 3; int grank = 0;
#pragma unroll
            for (int g2 = 0; g2 < 8; ++g2) { const float o = __builtin_bit_cast(float, __builtin_amdgcn_readlane(__builtin_bit_cast(int, gs), g2 * 8)); grank += (o > gs || (o == gs && g2 < myg)) ? 1 : 0; }
            const float masked = grank < 4 ? biased : -INFINITY; int rank = 0;
#pragma unroll
            for (int e2 = 0; e2 < 64; ++e2) { const float o = __builtin_bit_cast(float, __builtin_amdgcn_readlane(__builtin_bit_cast(int, masked), e2)); rank += (o > masked || (o == masked && e2 < lane)) ? 1 : 0; }
            const float wsel = rank < 6 ? s : 0.f; const float tot = wave_sum(wsel);
            const int ri = gi * 16 + lr;
            selm[ri * 64 + lane] = (rank < 6) ? 1 : 0; rkm[ri * 64 + lane] = (unsigned char)rank; wtm[ri * 64 + lane] = wsel / tot * 2.5f; }
        __syncthreads();
    }
    const int nrows = gi * 16;
    if (wave == 0) { unsigned n = 0;
        for (int r = 0; r < nrows; ++r) n += selm[r * 64 + lane];
        unsigned base = 0; if (n && !(PROBE_NOATOM && cnt_shift)) base = __hip_atomic_fetch_add(cnt + 64 * lane, n, __ATOMIC_RELAXED, __HIP_MEMORY_SCOPE_AGENT);
        basem[lane] = base; }
    __syncthreads();
    for (int ri = wave; ri < nrows; ri += 8) { unsigned pos = basem[lane];
        for (int r = 0; r < ri; ++r) pos += selm[r * 64 + lane];
        if (selm[ri * 64 + lane]) { const size_t m = (size_t)(wg + (ri >> 4) * G) * 16 + (ri & 15); const int rk = rkm[ri * 64 + lane];
            LIST[lane * T + pos] = (int)m; WL[lane * T + pos] = wtm[ri * 64 + lane]; SLOT[m * 8 + rk] = ((unsigned)lane << 16) | pos; } }
    __syncthreads();
}
__device__ __forceinline__ void phase_combine_ln2(const Params& p, int l, float* dst, int gw, int NGW, int lane) {
    const float* X1 = (const float*)(p.ws + WS_X1); const bf16* YE = (const bf16*)(p.ws + WS_YEXP); const unsigned* SLOT = (const unsigned*)(p.ws + WS_SLOT);
    const unsigned* cnt = (const unsigned*)(p.ws + WS_CTL) + CW_CNT + l * 4096;
    const float* g2 = p.in[I_LN2G] + (size_t)l * D; const float* b2 = p.in[I_LN2B] + (size_t)l * D;
    const int tiles = ((int)cnt[64 * lane] + 255) >> 8; const float incl = wave_scan_incl((float)tiles);
    const int toff = (int)incl - tiles;
    const int tsh = __builtin_amdgcn_readlane((int)incl, 63);
    for (int m = gw; m < T; m += NGW) {
        v4f v[8]; const v4f* xr = (const v4f*)(X1 + (size_t)m * D) + lane;
#pragma unroll
        for (int j = 0; j < 8; ++j) v[j] = xr[64 * j] * ALPHA;
#pragma unroll
        for (int k = 0; k < 7; ++k) { size_t row;
            if (k == 0) row = (size_t)tsh * 256 + m;
            else { const unsigned s = __builtin_amdgcn_readfirstlane(SLOT[(size_t)m * 8 + (k - 1)]); const int e = (int)(s >> 16); row = (size_t)__builtin_amdgcn_readlane(toff, e) * 256 + (s & 0xffffu); }
            const v2u* yr = (const v2u*)(YE + row * D) + lane;
#pragma unroll
            for (int j = 0; j < 8; ++j) { const v2u y = yr[64 * j]; v[j].x += bflo(y.x); v[j].y += bfhi(y.x); v[j].z += bflo(y.y); v[j].w += bfhi(y.y); } }
        float s = 0.f;
#pragma unroll
        for (int j = 0; j < 8; ++j) s += (v[j].x + v[j].y) + (v[j].z + v[j].w);
        const float mean = wave_sum(s) * (1.f / D); float s2 = 0.f;
#pragma unroll
        for (int j = 0; j < 8; ++j) { v[j] = v[j] - mean; s2 += (v[j].x * v[j].x + v[j].y * v[j].y) + (v[j].z * v[j].z + v[j].w * v[j].w); }
        const float rstd = rsqrtf(wave_sum(s2) * (1.f / D) + LN_EPS);
        v4f* xo = (v4f*)(dst + (size_t)m * D) + lane;
#pragma unroll
        for (int j = 0; j < 8; ++j) { const v4f gg = ((const v4f*)g2)[lane + 64 * j], bb = ((const v4f*)b2)[lane + 64 * j]; xo[64 * j] = v[j] * rstd * gg + bb; }
    }
}

constexpr int NPH = 11;
template <class S> struct DupOrder {
    S s; int n;
    __device__ __forceinline__ bool next(int i, Unit& u) const { return s.next(i >= n ? i - n : i, u); }
    __device__ __forceinline__ int row_token(int i, int r) const { return s.row_token(i >= n ? i - n : i, r); }
    __device__ __forceinline__ void a_ready(const Unit& u) const { s.a_ready(u); }
    __device__ __forceinline__ void done(const Unit& u) const { s.done(u); }
};
template <class S> __device__ __forceinline__ int count_units(const S& s) { Unit u; int n = 0; while (n < 64 && s.next(n, u)) ++n; return n; }
#define ORDER_T(k, T) typename std::conditional<PROBE_DUP == (k), DupOrder<T>, T>::type
template <class S> __device__ __forceinline__ DupOrder<S> make_order(const S& s, std::true_type) { DupOrder<S> d{s, count_units(s)}; d.n = count_units(s); return d; }
template <class S> __device__ __forceinline__ S make_order(const S& s, std::false_type) { return s; }
#define MAKE_ORDER(k, s) make_order(s, std::integral_constant<bool, PROBE_DUP == (k)>())
template <int l>
__device__ __forceinline__ void run_layer(const Params& p, LAS unsigned char* lds, const XcdBarrier& bar, int tid, int lane, int wave, int G, int wg, int gw, int NGW) {
    unsigned char* ws = p.ws;
    {
        const float* xin = (l == 0) ? p.in[I_X] : (const float*)(ws + WS_XCUR);
        float* xout = (l == NL - 1) ? p.out : (float*)(ws + WS_XCUR);
#ifndef PROBE_DUP
#define PROBE_DUP (-1)
#endif
#define IS_GEMM_PH(k) ((k) == 1 || (k) == 5 || (k) == 6 || (k) == 8 || (k) == 9)
#define REP(k) _Pragma("nounroll") for (int _r = 0; _r < ((PROBE_DUP == (k) && !IS_GEMM_PH(k)) ? 2 + (p.ph_lo >> 20) : 1); ++_r)
#ifndef PH_MASK
#define PH_MASK 0x7ff
#endif
#define RUN(k) (((PH_MASK >> (k)) & 1) && p.ph_lo <= l * NPH + (k) && l * NPH + (k) < p.ph_hi)
#define SEAM(k) do { if (l * NPH + (k) + 1 < p.ph_hi) xcd_barrier(bar); } while (0)
        if (RUN(0)) { REP(0) { phase_convert<0>(p, l, lds, gw, NGW, wave, lane);
#if defined(PROBE_CONV0)
            phase_convert<1>(p, l, lds, gw, NGW, wave, lane);
#endif
 phase_xprep(p, l, xin, lds, gw, NGW, tid, lane); } SEAM(0); }
        if (RUN(1)) { REP(1) { pg8::Gemm g{(const bf16*)(ws + WS_XB), (const bf16*)(ws + WS_WIN), T, ZC, D / 2, D / 2, D / 2}; pg8::StaticOrder S; S.init(T, ZC, G, wg);
            pg8::EpiBf16<0> E{(bf16*)(ws + WS_Z), ZC, nullptr, 0, 0, 1.f / 64.f};
            auto S2 = MAKE_ORDER(1, S); pg8::gemm_phase<pg8::EpiBf16<0>, ORDER_T(1, pg8::StaticOrder), true, true, true>(lds, g, S2, E); } SEAM(1); }
        if (RUN(2)) { REP(2) { for (int it = wg; it < 1536; it += G) { if (it < 512) gdn_pre_item(p, l, lds, it, tid, wave, lane); else if (it < 1024) ml_pre_item(p, l, lds, it - 512, tid, wave, lane); else vt_item(p, lds, it - 1024, tid); } } SEAM(2); }
        if (RUN(3)) { REP(3) { phase_mixers(p, l, lds, wg, G, tid, wave, lane, bar); } SEAM(3); }
        if (RUN(4)) { REP(4) { phase_post(p, l, gw, NGW, lane); } SEAM(4); }
        if (RUN(5)) { REP(5) { pg8::Gemm g{(const bf16*)(ws + WS_BR), (const bf16*)(ws + WS_WBR), T, D, BRW, BRW, BRW}; pg8::StaticOrder S; S.init(T, D, G, wg);
            EpiMergeH E{(const bf16*)(ws + WS_Z), (bf16*)(ws + WS_MSUM)};
            auto S2 = MAKE_ORDER(5, S); pg8::gemm_phase<EpiMergeH, ORDER_T(5, pg8::StaticOrder), true, true>(lds, g, S2, E); } SEAM(5); }
        if (RUN(6)) { REP(6) { pg8::Gemm g{(const bf16*)(ws + WS_MSUM), (const bf16*)(ws + WS_WOUT), T, D, D / 2, D / 2, D / 2}; pg8::StaticOrder S; S.init(T, D, G, wg);
            EpiResid E{xin, (float*)(ws + WS_Y), 1.f / 64.f};
            auto S2 = MAKE_ORDER(6, S); pg8::gemm_phase<EpiResid, ORDER_T(6, pg8::StaticOrder), true, true, true>(lds, g, S2, E); } SEAM(6); }
        if (RUN(7)) { REP(7) { phase_ln1_router(p, l, lds, wg, G, wave, lane, (PROBE_DUP == 7 && _r == 0) ? 16384 : 0); } SEAM(7); }
        if (RUN(8)) { REP(8) { const unsigned* cnt = (const unsigned*)(ws + WS_CTL) + CW_CNT + l * 4096; MoeTab M(lds); moe_tables(M, cnt, tid, lane, wave);
            UpOrder S{M, 0}; S.n = up_order_build(M, (const int*)(ws + WS_LIST), (const float*)(ws + WS_WL), wg, G, tid);
            constexpr int KU = MOE_UP_FP8 ? D / 2 : D;
            pg8::Gemm g{(const bf16*)(ws + WS_X1B), (const bf16*)(ws + WS_WUP), T, NEX * 1024, KU, KU, KU};
            EpiGluSparse E{(LAS const float*)M.wt, (bf16*)(ws + WS_HB)};
            auto S2 = MAKE_ORDER(8, S); pg8::gemm_phase_gather<EpiGluSparse, ORDER_T(8, UpOrder), MOE_UP_FP8 != 0>(lds, g, S2, E); } SEAM(8); }
        if (RUN(9)) { REP(9) { const unsigned* cnt = (const unsigned*)(ws + WS_CTL) + CW_CNT + l * 4096; MoeTab M(lds); moe_tables(M, cnt, tid, lane, wave);
            DownOrder S{M, G, wg, 8 * M.t[65]};
            constexpr int KD = MOE_DN_FP8 ? ED / 2 : ED;
            pg8::Gemm g{(const bf16*)(ws + WS_HB), (const bf16*)(ws + WS_WDN), HROWS, NEX * D, KD, KD, KD};
            EpiYexp E{(bf16*)(ws + WS_YEXP)};
            auto S2 = MAKE_ORDER(9, S); pg8::gemm_phase<EpiYexp, ORDER_T(9, DownOrder), true, true, MOE_DN_FP8 != 0>(lds, g, S2, E); } SEAM(9); }
        if (RUN(10)) { REP(10) { phase_combine_ln2(p, l, xout, gw, NGW, lane); } SEAM(10); }
#undef RUN
#undef SEAM
    }
}
__global__ void __launch_bounds__(512, 2) fwd_kernel(Params p) {
    extern __shared__ __attribute__((aligned(16))) unsigned char lds_raw[];
    LAS unsigned char* lds = (LAS unsigned char*)lds_raw;
    const int tid = threadIdx.x, lane = tid & 63, wave = __builtin_amdgcn_readfirstlane(tid >> 6);
    const int G = gridDim.x, wg = blockIdx.x, gw = wg * 8 + wave, NGW = G * 8;
    volatile LAS unsigned* MISC = (volatile LAS unsigned*)(lds + MISC_OFF);
    if (tid < 32) MISC[tid] = 0u;
    __syncthreads();
    unsigned* ctl = (unsigned*)(p.ws + WS_CTL);
    const bool multi = (p.ph_hi - p.ph_lo) > 1;
    XcdBarrier bar; bar.bar = ctl + CW_BAR; bar.x = 0; bar.st = nullptr;
    if (multi) bar = xcd_barrier_post(ctl + CW_BAR, MISC + 8);
    run_layer<0>(p, lds, bar, tid, lane, wave, G, wg, gw, NGW);
    run_layer<1>(p, lds, bar, tid, lane, wave, G, wg, gw, NGW);
}

#ifndef MK_MULTI_LAUNCH
#define MK_MULTI_LAUNCH 0
#endif
extern "C" void kernel_launch(void* const* d_in, const int* in_sizes, int n_in, void* d_out, int out_size, void* d_ws, size_t ws_size, hipStream_t stream) {
    static int grid = 0;
    if (grid == 0) {
        if (n_in != 27 || out_size != T * D || ws_size < WS_END) { fprintf(stderr, "kernel_launch: unexpected shapes (n_in %d out %d ws %zu need %zu)\n", n_in, out_size, ws_size, (size_t)WS_END); grid = -1; return; }
        int dev = 0, cus = 0, per_cu = 0;
        if (hipGetDevice(&dev) != hipSuccess || hipDeviceGetAttribute(&cus, hipDeviceAttributeMultiprocessorCount, dev) != hipSuccess) { grid = -1; return; }
        if (hipFuncSetAttribute((const void*)fwd_kernel, hipFuncAttributeMaxDynamicSharedMemorySize, LDS_BYTES) != hipSuccess) { fprintf(stderr, "kernel_launch: hipFuncSetAttribute failed\n"); grid = -1; return; }
        if (hipOccupancyMaxActiveBlocksPerMultiprocessor(&per_cu, (const void*)fwd_kernel, 512, LDS_BYTES) != hipSuccess || per_cu < 1) { fprintf(stderr, "kernel_launch: occupancy query says %d\n", per_cu); }
        (void)hipGetLastError();
        grid = cus;
    }
    if (grid < 0) return;
    (void)hipMemsetAsync((char*)d_ws + WS_CTL, 0, CTL_ZERO_BYTES, stream);
    Params p{};
    for (int i = 0; i < 27; ++i) p.in[i] = (const float*)d_in[i];
    p.out = (float*)d_out; p.ws = (unsigned char*)d_ws;
#if MK_MULTI_LAUNCH
    for (int ph = 0; ph < NL * NPH; ++ph) { p.ph_lo = ph; p.ph_hi = ph + 1; hipLaunchKernelGGL(fwd_kernel, dim3(grid), dim3(512), LDS_BYTES, stream, p); }
#else
    p.ph_lo = 0; p.ph_hi = NL * NPH; hipLaunchKernelGGL(fwd_kernel, dim3(grid), dim3(512), LDS_BYTES, stream, p);
#endif
}
```

```cpp
#include <hip/hip_runtime.h>
#include <cstdio>
#include <cstdint>
#include <type_traits>
namespace pg8 {
#define PG8_LAS __attribute__((address_space(3)))
typedef unsigned short bf16_t;
typedef short bf16x8 __attribute__((ext_vector_type(8)));
typedef float f32x4 __attribute__((ext_vector_type(4)));
typedef unsigned u32x4 __attribute__((ext_vector_type(4)));
constexpr int BM = 256, BK = 64, HALF = 128, HTB = HALF * BK * 2  , STAGE_BYTES = 8 * HTB, NXCD = 8, WGM = 8;

__host__ __device__ __forceinline__ int lds_byte(int r, int c) { const int st = (r >> 4) * 2 + (c >> 5), rr = r & 15, cc = c & 31, ob = rr * 64 + cc * 2; return st * 1024 + (ob ^ (((ob >> 9) & 1) << 5)); }
__host__ __device__ __forceinline__ void stage_rc(int b, int& R, int& C) { const int st = b / 1024, sb = b % 1024, swz = sb ^ (((sb >> 9) & 1) << 5); R = (st >> 1) * 16 + swz / 64; C = (st & 1) * 32 + (swz % 64) / 2; }
__host__ __device__ __forceinline__ int perm32(int rho) { const int n = rho >> 4, i = rho & 15; return 8 * (i >> 2) + 4 * n + (i & 3); }

struct Unit { int pm, pn, aux; };
struct Gemm { const bf16_t* A; const bf16_t* Bt; int M, N, K, lda, ldb; };

struct StaticOrder {
    int nM, nN, nwg, G, c;
    __host__ __device__ void init(int M, int N, int G_, int c_) { nM = M / BM; nN = N / BM; nwg = nM * nN; G = G_; c = c_; }
    __host__ __device__ bool next(int i, Unit& u) const {
        const long L = (long)i * G + c; if (L >= nwg) return false;
        int wgid = (int)L; { const int q = nwg / NXCD, r = nwg % NXCD, xcd = wgid % NXCD, off = wgid / NXCD; wgid = (xcd < r ? xcd * (q + 1) : r * (q + 1) + (xcd - r) * q) + off; }
        const int nig = WGM * nN, gid = wgid / nig, fm = gid * WGM, gsz = (nM - fm) < WGM ? (nM - fm) : WGM;
        u.pm = fm + ((wgid % nig) % gsz); u.pn = (wgid % nig) / gsz; return true;
    }
    __device__ __forceinline__ void a_ready(const Unit&) const {}
    __device__ __forceinline__ void done(const Unit&) const {}
};

__device__ __forceinline__ unsigned cvt_pk_bf16(float lo, float hi) { unsigned r; asm volatile("v_cvt_pk_bf16_f32 %0, %1, %2" : "=v"(r) : "v"(lo), "v"(hi)); return r; }
typedef float f32x2 __attribute__((ext_vector_type(2)));
__device__ __forceinline__ f32x2 gelu_pk(f32x2 v) {
    const f32x2 av = __builtin_elementwise_abs(v), d = av * 0.2316418882f + 1.0f;
    f32x2 t; t.x = __builtin_amdgcn_rcpf(d.x); t.y = __builtin_amdgcn_rcpf(d.y);
    f32x2 q = t * 0.5307027145f + (-0.7265760135f); q = q * t + 0.7107068705f; q = q * t + (-0.142248368f); q = q * t + 0.127414796f; q = q * t;
    const f32x2 s = (v * v) * (-0.72134752044f);
    f32x2 e; e.x = __builtin_amdgcn_exp2f(s.x); e.y = __builtin_amdgcn_exp2f(s.y);
    const f32x2 m = v * (q * e), r = v - m;
    f32x2 o; o.x = v.x < 0.f ? m.x : r.x; o.y = v.y < 0.f ? m.y : r.y; return o;
}

template <int ACT  > struct EpiBf16 {
    static constexpr bool PERM = true, AFTER_DRAIN = false; static constexpr int MID = 0; static_assert(ACT == 0 || ACT == 1, "EpiBf16: ACT is 0 (none) or 1 (gelu_pk)");
    bf16_t* O; int ldc; const float* bias; int split_cols; size_t split_stride; float scale0;
    __device__ __forceinline__ void operator()(const f32x4 (&acc)[2][2][4][2], const Unit& u, int wr, int wc, int fr, int fq) const {
        const int row0 = u.pm * BM + wr * 64 + fr; int colt = u.pn * BM; bf16_t* base = O;
        float sc = scale0; if (split_cols) { const int t = colt / split_cols; base += (size_t)t * split_stride; colt -= t * split_cols; if (t != 0) sc = 1.f; }
        const int col0 = colt + wc * 32 + 8 * fq, bcol0 = u.pn * BM + wc * 32 + 8 * fq;
        f32x4 bv[2][2];
#pragma unroll
        for (int bj = 0; bj < 2; ++bj)
#pragma unroll
            for (int n = 0; n < 2; ++n) bv[bj][n] = bias ? *(const f32x4*)(bias + bcol0 + bj * HALF + 4 * n) : (f32x4){0.f, 0.f, 0.f, 0.f};
#pragma unroll
        for (int ai = 0; ai < 2; ++ai)
#pragma unroll
            for (int m = 0; m < 4; ++m) { bf16_t* rowp = base + (size_t)(row0 + ai * HALF + m * 16) * ldc + col0;
#pragma unroll
                for (int bj = 0; bj < 2; ++bj) { f32x4 v0 = acc[ai][bj][m][0] + bv[bj][0], v1 = acc[ai][bj][m][1] + bv[bj][1];
                    if (ACT == 1) { f32x2 a = gelu_pk((f32x2){v0[0], v0[1]}), b = gelu_pk((f32x2){v0[2], v0[3]}), c = gelu_pk((f32x2){v1[0], v1[1]}), d = gelu_pk((f32x2){v1[2], v1[3]});
                        v0 = (f32x4){a.x, a.y, b.x, b.y}; v1 = (f32x4){c.x, c.y, d.x, d.y}; }
                    v0 = v0 * sc; v1 = v1 * sc; u32x4 w; w.x = cvt_pk_bf16(v0[0], v0[1]); w.y = cvt_pk_bf16(v0[2], v0[3]); w.z = cvt_pk_bf16(v1[0], v1[1]); w.w = cvt_pk_bf16(v1[2], v1[3]);
                    *(u32x4*)(rowp + bj * HALF) = w; } }
    }
};

typedef int i32x8 __attribute__((ext_vector_type(8)));
__device__ __forceinline__ i32x8 cat8(const bf16x8 a, const bf16x8 b) { typedef int i32x4 __attribute__((ext_vector_type(4))); const i32x4 x = __builtin_bit_cast(i32x4, a), y = __builtin_bit_cast(i32x4, b); return (i32x8){x[0], x[1], x[2], x[3], y[0], y[1], y[2], y[3]}; }
__device__ __forceinline__ bf16x8 lo8(const i32x8 v) { typedef int i32x4 __attribute__((ext_vector_type(4))); return __builtin_bit_cast(bf16x8, __builtin_shufflevector(v, v, 0, 1, 2, 3)); }
__device__ __forceinline__ bf16x8 hi8(const i32x8 v) { typedef int i32x4 __attribute__((ext_vector_type(4))); return __builtin_bit_cast(bf16x8, __builtin_shufflevector(v, v, 4, 5, 6, 7)); }
template <class Epi, class Sched, bool ALIGN_EPI = false, bool SP2 = false, bool FP8 = false>
__device__ __forceinline__ void gemm_phase(PG8_LAS unsigned char* lds, const Gemm g, const Sched& S, const Epi& E) {
    const int tid = threadIdx.x, wid = __builtin_amdgcn_readfirstlane(tid >> 6), lane = tid & 63, wr = wid >> 2, wc = wid & 3, fr = lane & 15, fq = lane >> 4;
    const int K = g.K, nt = K / BK;
    unsigned voffA[2], voffB[2];
#pragma unroll
    for (int i = 0; i < 2; ++i) { int R, C; stage_rc(tid * 16 + i * 8192, R, C); const int Rb = Epi::PERM ? ((R & ~31) + perm32(R & 31)) : R;
        voffA[i] = (unsigned)(R * g.lda + C) * 2u; voffB[i] = (unsigned)(Rb * g.ldb + C) * 2u; }
    const size_t kstep = (size_t)(BK * 2);
    const size_t hstepA = (size_t)HALF * g.lda * 2, hstepB = (size_t)HALF * g.ldb * 2;
    const size_t tstepA = 2 * hstepA, tstepB = 2 * hstepB;
    const unsigned ldsw = (unsigned)wid * 1024u;
    const int aoff = lds_byte(wr * 64 + fr, fq * 8), boff = lds_byte(wc * 32 + fr, fq * 8);
#define PG8_SA(b, h) (((b) * 2 + (h)) * HTB)
#define PG8_SB(b, h) ((4 + (b) * 2 + (h)) * HTB)
#define PG8_STAGE(bufoff, gbase, voff) do { _Pragma("unroll") for (int _i = 0; _i < 2; ++_i) \
        __builtin_amdgcn_global_load_lds((const unsigned*)((const char*)(gbase) + (voff)[_i]), (PG8_LAS unsigned*)(lds + (bufoff) + ldsw + _i * 8192), 16, 0, 0); } while (0)
#define PG8_LDA(dst, b, h) do { _Pragma("unroll") for (int m = 0; m < 4; ++m) { if constexpr (FP8) dst##8[m] = cat8(*(const PG8_LAS bf16x8*)(lds + PG8_SA(b, h) + aoff + m * 2048), *(const PG8_LAS bf16x8*)(lds + PG8_SA(b, h) + aoff + m * 2048 + 1024)); \
        else { _Pragma("unroll") for (int k = 0; k < 2; ++k) dst[m][k] = *(const PG8_LAS bf16x8*)(lds + PG8_SA(b, h) + aoff + m * 2048 + k * 1024); } } } while (0)
#define PG8_LDB(dst, b, h) do { _Pragma("unroll") for (int n = 0; n < 2; ++n) { if constexpr (FP8) dst##8[n] = cat8(*(const PG8_LAS bf16x8*)(lds + PG8_SB(b, h) + boff + n * 2048), *(const PG8_LAS bf16x8*)(lds + PG8_SB(b, h) + boff + n * 2048 + 1024)); \
        else { _Pragma("unroll") for (int k = 0; k < 2; ++k) dst[n][k] = *(const PG8_LAS bf16x8*)(lds + PG8_SB(b, h) + boff + n * 2048 + k * 1024); } } } while (0)
#define PG8_MMA(ai, bj, At, Bt) do { __builtin_amdgcn_s_setprio(1); _Pragma("unroll") for (int m = 0; m < 4; ++m) _Pragma("unroll") for (int n = 0; n < 2; ++n) { \
        if constexpr (FP8) asm volatile("v_mfma_scale_f32_16x16x128_f8f6f4 %0, %1, %2, %0, %3, %3 op_sel_hi:[0,0,0]" : "+v"(acc[ai][bj][m][n]) : "v"(Bt##8[n]), "v"(At##8[m]), "v"(fp8_unit_scale)); \
        else { _Pragma("unroll") for (int k = 0; k < 2; ++k) acc[ai][bj][m][n] = __builtin_amdgcn_mfma_f32_16x16x32_bf16(Bt[n][k], At[m][k], acc[ai][bj][m][n], 0, 0, 0); } } __builtin_amdgcn_s_setprio(0); } while (0)
#define PG8_WAIT_V(n) asm volatile("s_waitcnt vmcnt(" #n ")" ::: "memory")
#define PG8_WAIT_L(n) asm volatile("s_waitcnt lgkmcnt(" #n ")" ::: "memory")
#define PG8_BAR __builtin_amdgcn_s_barrier()
#define PG8_SCHED __builtin_amdgcn_sched_barrier(0)
    Unit cur, nxt; int ui = 0;
    if (!S.next(0, cur)) return;
    f32x4 acc[2][2][4][2];
#pragma unroll
    for (int a = 0; a < 2; ++a)
#pragma unroll
        for (int b = 0; b < 2; ++b)
#pragma unroll
            for (int m = 0; m < 4; ++m)
#pragma unroll
                for (int n = 0; n < 2; ++n) acc[a][b][m][n] = (f32x4){0.f, 0.f, 0.f, 0.f};
    int fp8_unit_scale = 0x7F7F7F7F; asm volatile("" : "+v"(fp8_unit_scale));
    bf16x8 At[4][2], B0[2][2], B1[2][2];
    i32x8 At8[4], B08[2], B18[2];
    const char* cA = (const char*)g.A + (size_t)cur.pm * tstepA; const char* cB = (const char*)g.Bt + (size_t)cur.pn * tstepB;
    S.a_ready(cur);
    if constexpr (SP2) {
        PG8_STAGE(PG8_SB(0, 0), cB, voffB); PG8_STAGE(PG8_SB(0, 1), cB + hstepB, voffB); PG8_STAGE(PG8_SA(0, 0), cA, voffA); PG8_STAGE(PG8_SA(0, 1), cA + hstepA, voffA);
        if (wr == 1) PG8_BAR;
        PG8_WAIT_V(2); PG8_BAR;
        PG8_STAGE(PG8_SB(1, 0), cB + kstep, voffB); PG8_STAGE(PG8_SA(1, 0), cA + kstep, voffA); PG8_STAGE(PG8_SB(1, 1), cB + hstepB + kstep, voffB);
        PG8_WAIT_V(6); PG8_BAR;
    } else {
        PG8_STAGE(PG8_SB(0, 0), cB, voffB); PG8_STAGE(PG8_SA(0, 0), cA, voffA); PG8_STAGE(PG8_SB(0, 1), cB + hstepB, voffB); PG8_STAGE(PG8_SA(0, 1), cA + hstepA, voffA);
        if (wr == 1) PG8_BAR;
        PG8_WAIT_V(4); PG8_BAR;
        PG8_STAGE(PG8_SB(1, 0), cB + kstep, voffB); PG8_STAGE(PG8_SA(1, 0), cA + kstep, voffA); PG8_STAGE(PG8_SB(1, 1), cB + hstepB + kstep, voffB);
        PG8_WAIT_V(6); PG8_BAR;
    }
    for (;;) {
        const bool has_next = S.next(ui + 1, nxt);
        const char* nA = has_next ? (const char*)g.A + (size_t)nxt.pm * tstepA : cA; const char* nB = has_next ? (const char*)g.Bt + (size_t)nxt.pn * tstepB : cB;
        for (int t = 0; t < nt; t += 2) {
            const bool last = (t == nt - 2);
            const char* a1 = cA + (size_t)(t + 1) * kstep;
            const char* a2 = last ? nA : cA + (size_t)(t + 2) * kstep; const char* b2 = last ? nB : cB + (size_t)(t + 2) * kstep;
            const char* a3 = a2 + kstep; const char* b3 = b2 + kstep;
            if (last && has_next) S.a_ready(nxt);
            if constexpr (SP2) {
            if constexpr (Epi::MID > 0) { if (t != 0 && (t % Epi::MID) == 0) { PG8_SCHED; if constexpr (FP8) asm volatile("s_nop 7\n\ts_nop 7" ::: "memory"); E.mid(acc, cur, t / Epi::MID, wr, wc, fr, fq); if constexpr (FP8) asm volatile("s_nop 7" ::: "memory"); PG8_SCHED; } }
            PG8_LDB(B0, 0, 0); PG8_LDB(B1, 0, 1); PG8_SCHED; PG8_LDA(At, 0, 0); PG8_STAGE(PG8_SA(1, 1), a1 + hstepA, voffA);
            PG8_WAIT_V(8); PG8_WAIT_L(0); PG8_BAR; PG8_MMA(0, 0, At, B0); PG8_MMA(0, 1, At, B1); PG8_BAR; PG8_SCHED;
            PG8_LDA(At, 0, 1); PG8_STAGE(PG8_SB(0, 0), b2, voffB); PG8_STAGE(PG8_SB(0, 1), b2 + hstepB, voffB); PG8_STAGE(PG8_SA(0, 0), a2, voffA);
            PG8_WAIT_V(8); PG8_WAIT_L(0); PG8_BAR; PG8_MMA(1, 0, At, B0); PG8_MMA(1, 1, At, B1); PG8_BAR; PG8_SCHED;
            PG8_LDB(B0, 1, 0); PG8_LDB(B1, 1, 1); PG8_SCHED; PG8_LDA(At, 1, 0); PG8_STAGE(PG8_SA(0, 1), a2 + hstepA, voffA);
            PG8_WAIT_V(8); PG8_WAIT_L(0); PG8_BAR; PG8_MMA(0, 0, At, B0); PG8_MMA(0, 1, At, B1); PG8_BAR; PG8_SCHED;
            PG8_LDA(At, 1, 1); PG8_STAGE(PG8_SB(1, 0), b3, voffB); PG8_STAGE(PG8_SB(1, 1), b3 + hstepB, voffB); PG8_STAGE(PG8_SA(1, 0), a3, voffA);
            PG8_WAIT_V(8); PG8_WAIT_L(0); PG8_BAR; PG8_MMA(1, 0, At, B0); PG8_MMA(1, 1, At, B1); PG8_BAR; PG8_SCHED;
            } else {
            PG8_LDB(B0, 0, 0); PG8_SCHED; PG8_LDA(At, 0, 0); PG8_STAGE(PG8_SA(1, 1), a1 + hstepA, voffA);
            PG8_WAIT_L(8); PG8_BAR; PG8_WAIT_L(0); PG8_MMA(0, 0, At, B0); PG8_BAR; PG8_SCHED;
            PG8_LDB(B1, 0, 1); PG8_STAGE(PG8_SB(0, 0), b2, voffB);
            PG8_BAR; PG8_WAIT_L(0); PG8_MMA(0, 1, At, B1); PG8_BAR;
            PG8_LDA(At, 0, 1); PG8_STAGE(PG8_SA(0, 0), a2, voffA);
            PG8_BAR; PG8_WAIT_L(0); PG8_MMA(1, 0, At, B0); PG8_BAR; PG8_SCHED;
            PG8_STAGE(PG8_SB(0, 1), b2 + hstepB, voffB);
            PG8_WAIT_V(6); PG8_BAR; PG8_MMA(1, 1, At, B1); PG8_BAR;
            PG8_LDB(B0, 1, 0); PG8_SCHED; PG8_LDA(At, 1, 0); PG8_STAGE(PG8_SA(0, 1), a2 + hstepA, voffA);
            PG8_WAIT_L(8); PG8_BAR; PG8_WAIT_L(0); PG8_MMA(0, 0, At, B0); PG8_BAR; PG8_SCHED;
            PG8_LDB(B1, 1, 1); PG8_STAGE(PG8_SB(1, 0), b3, voffB);
            PG8_BAR; PG8_WAIT_L(0); PG8_MMA(0, 1, At, B1); PG8_BAR;
            PG8_LDA(At, 1, 1); PG8_STAGE(PG8_SA(1, 0), a3, voffA);
            PG8_BAR; PG8_WAIT_L(0); PG8_MMA(1, 0, At, B0); PG8_BAR; PG8_SCHED;
            PG8_STAGE(PG8_SB(1, 1), b3 + hstepB, voffB);
            PG8_WAIT_V(6); PG8_BAR; PG8_MMA(1, 1, At, B1); PG8_BAR;
            }
        }
        if constexpr (ALIGN_EPI) { if (wr == 0) PG8_BAR; }
        if constexpr (FP8) asm volatile("s_nop 7\n\ts_nop 7" ::: "memory");
        if constexpr (!Epi::AFTER_DRAIN) { E(acc, cur, wr, wc, fr, fq); S.done(cur); }
        if (!has_next) break;
#pragma unroll
        for (int a = 0; a < 2; ++a)
#pragma unroll
            for (int b = 0; b < 2; ++b)
#pragma unroll
                for (int m = 0; m < 4; ++m)
#pragma unroll
                    for (int n = 0; n < 2; ++n) acc[a][b][m][n] = (f32x4){0.f, 0.f, 0.f, 0.f};
        cur = nxt; cA = nA; cB = nB; ++ui;
        if constexpr (ALIGN_EPI) { if (wr == 1) PG8_BAR; }
    }
    PG8_WAIT_V(0);
    if constexpr (!ALIGN_EPI) { if (wr == 0) PG8_BAR; }
    PG8_BAR;
    if constexpr (Epi::AFTER_DRAIN) { E.fused(acc, cur, wr, wc, fr, fq, lds, wid, lane); S.done(cur); }
#undef PG8_SA
#undef PG8_SB
#undef PG8_STAGE
#undef PG8_LDA
#undef PG8_LDB
#undef PG8_MMA
#undef PG8_WAIT_V
#undef PG8_WAIT_L
#undef PG8_BAR
#undef PG8_SCHED
}
template <class Epi, class Sched, bool FP8 = false>
__device__ __forceinline__ void gemm_phase_gather(PG8_LAS unsigned char* lds, const Gemm g, const Sched& S, const Epi& E) {
    const int tid = threadIdx.x, wid = __builtin_amdgcn_readfirstlane(tid >> 6), lane = tid & 63, wr = wid >> 2, wc = wid & 3, fr = lane & 15, fq = lane >> 4;
    const int K = g.K, nt = K / BK;
    unsigned voffB[2]; int RA[2], CA[2];
#pragma unroll
    for (int i = 0; i < 2; ++i) { int R, C; stage_rc(tid * 16 + i * 8192, R, C); const int Rb = Epi::PERM ? ((R & ~31) + perm32(R & 31)) : R;
        RA[i] = R; CA[i] = C; voffB[i] = (unsigned)(Rb * g.ldb + C) * 2u; }
    const size_t kstep = (size_t)(BK * 2);
    const size_t hstepB = (size_t)HALF * g.ldb * 2, tstepB = 2 * hstepB;
    const unsigned ldsw = (unsigned)wid * 1024u;
    const int aoff = lds_byte(wr * 64 + fr, fq * 8), boff = lds_byte(wc * 32 + fr, fq * 8);
#define PG8_SA(b, h) (((b) * 2 + (h)) * HTB)
#define PG8_SB(b, h) ((4 + (b) * 2 + (h)) * HTB)
#define PG8_STAGE(bufoff, gbase, voff) do { _Pragma("unroll") for (int _i = 0; _i < 2; ++_i) \
        __builtin_amdgcn_global_load_lds((const unsigned*)((const char*)(gbase) + (voff)[_i]), (PG8_LAS unsigned*)(lds + (bufoff) + ldsw + _i * 8192), 16, 0, 0); } while (0)
#define PG8_LDA(dst, b, h) do { _Pragma("unroll") for (int m = 0; m < 4; ++m) { if constexpr (FP8) dst##8[m] = cat8(*(const PG8_LAS bf16x8*)(lds + PG8_SA(b, h) + aoff + m * 2048), *(const PG8_LAS bf16x8*)(lds + PG8_SA(b, h) + aoff + m * 2048 + 1024)); \
        else { _Pragma("unroll") for (int k = 0; k < 2; ++k) dst[m][k] = *(const PG8_LAS bf16x8*)(lds + PG8_SA(b, h) + aoff + m * 2048 + k * 1024); } } } while (0)
#define PG8_LDB(dst, b, h) do { _Pragma("unroll") for (int n = 0; n < 2; ++n) { if constexpr (FP8) dst##8[n] = cat8(*(const PG8_LAS bf16x8*)(lds + PG8_SB(b, h) + boff + n * 2048), *(const PG8_LAS bf16x8*)(lds + PG8_SB(b, h) + boff + n * 2048 + 1024)); \
        else { _Pragma("unroll") for (int k = 0; k < 2; ++k) dst[n][k] = *(const PG8_LAS bf16x8*)(lds + PG8_SB(b, h) + boff + n * 2048 + k * 1024); } } } while (0)
#define PG8_MMA(ai, bj, At, Bt) do { __builtin_amdgcn_s_setprio(1); _Pragma("unroll") for (int m = 0; m < 4; ++m) _Pragma("unroll") for (int n = 0; n < 2; ++n) { \
        if constexpr (FP8) asm volatile("v_mfma_scale_f32_16x16x128_f8f6f4 %0, %1, %2, %0, %3, %3 op_sel_hi:[0,0,0]" : "+v"(acc[ai][bj][m][n]) : "v"(Bt##8[n]), "v"(At##8[m]), "v"(fp8_unit_scale)); \
        else { _Pragma("unroll") for (int k = 0; k < 2; ++k) acc[ai][bj][m][n] = __builtin_amdgcn_mfma_f32_16x16x32_bf16(Bt[n][k], At[m][k], acc[ai][bj][m][n], 0, 0, 0); } } __builtin_amdgcn_s_setprio(0); } while (0)
#define PG8_WAIT_V(n) asm volatile("s_waitcnt vmcnt(" #n ")" ::: "memory")
#define PG8_WAIT_L(n) asm volatile("s_waitcnt lgkmcnt(" #n ")" ::: "memory")
#define PG8_BAR __builtin_amdgcn_s_barrier()
#define PG8_SCHED __builtin_amdgcn_sched_barrier(0)
#define PG8_ROWS(dst, ui_) do { _Pragma("unroll") for (int _h = 0; _h < 2; ++_h) _Pragma("unroll") for (int _i = 0; _i < 2; ++_i) \
        dst[_h][_i] = (unsigned)S.row_token((ui_), _h * HALF + RA[_i]) * (unsigned)(g.lda * 2) + (unsigned)(CA[_i] * 2); } while (0)
    Unit cur, nxt; int ui = 0;
    if (!S.next(0, cur)) return;
    f32x4 acc[2][2][4][2];
#pragma unroll
    for (int a = 0; a < 2; ++a)
#pragma unroll
        for (int b = 0; b < 2; ++b)
#pragma unroll
            for (int m = 0; m < 4; ++m)
#pragma unroll
                for (int n = 0; n < 2; ++n) acc[a][b][m][n] = (f32x4){0.f, 0.f, 0.f, 0.f};
    int fp8_unit_scale = 0x7F7F7F7F; asm volatile("" : "+v"(fp8_unit_scale));
    bf16x8 At[4][2], B0[2][2], B1[2][2];
    i32x8 At8[4], B08[2], B18[2];
    unsigned offC[2][2];
    PG8_ROWS(offC, 0);
    const char* gA = (const char*)g.A;
    const char* cB = (const char*)g.Bt + (size_t)cur.pn * tstepB;
    PG8_STAGE(PG8_SB(0, 0), cB, voffB); PG8_STAGE(PG8_SB(0, 1), cB + hstepB, voffB); PG8_STAGE(PG8_SA(0, 0), gA, offC[0]); PG8_STAGE(PG8_SA(0, 1), gA, offC[1]);
    if (wr == 1) PG8_BAR;
    PG8_WAIT_V(2); PG8_BAR;
    PG8_STAGE(PG8_SB(1, 0), cB + kstep, voffB); PG8_STAGE(PG8_SA(1, 0), gA + kstep, offC[0]); PG8_STAGE(PG8_SB(1, 1), cB + hstepB + kstep, voffB);
    PG8_WAIT_V(6); PG8_BAR;
    for (;;) {
        const bool has_next = S.next(ui + 1, nxt);
        const char* nB = has_next ? (const char*)g.Bt + (size_t)nxt.pn * tstepB : cB;
        for (int t = 0; t < nt; t += 2) {
            const bool last = (t == nt - 2);
            const char* a1 = gA + (size_t)(t + 1) * kstep;
            const char* a2 = last ? gA : gA + (size_t)(t + 2) * kstep; const char* b2 = last ? nB : cB + (size_t)(t + 2) * kstep;
            const char* a3 = a2 + kstep; const char* b3 = b2 + kstep;
            PG8_LDB(B0, 0, 0); PG8_LDB(B1, 0, 1); PG8_SCHED; PG8_LDA(At, 0, 0); PG8_STAGE(PG8_SA(1, 1), a1, offC[1]);
            if (last && has_next) { PG8_ROWS(offC, ui + 1); }
            PG8_WAIT_V(8); PG8_WAIT_L(0); PG8_BAR; PG8_MMA(0, 0, At, B0); PG8_MMA(0, 1, At, B1); PG8_BAR; PG8_SCHED;
            PG8_LDA(At, 0, 1); PG8_STAGE(PG8_SB(0, 0), b2, voffB); PG8_STAGE(PG8_SB(0, 1), b2 + hstepB, voffB); PG8_STAGE(PG8_SA(0, 0), a2, offC[0]);
            PG8_WAIT_V(8); PG8_WAIT_L(0); PG8_BAR; PG8_MMA(1, 0, At, B0); PG8_MMA(1, 1, At, B1); PG8_BAR; PG8_SCHED;
            PG8_LDB(B0, 1, 0); PG8_LDB(B1, 1, 1); PG8_SCHED; PG8_LDA(At, 1, 0); PG8_STAGE(PG8_SA(0, 1), a2, offC[1]);
            PG8_WAIT_V(8); PG8_WAIT_L(0); PG8_BAR; PG8_MMA(0, 0, At, B0); PG8_MMA(0, 1, At, B1); PG8_BAR; PG8_SCHED;
            PG8_LDA(At, 1, 1); PG8_STAGE(PG8_SB(1, 0), b3, voffB); PG8_STAGE(PG8_SB(1, 1), b3 + hstepB, voffB); PG8_STAGE(PG8_SA(1, 0), a3, offC[0]);
            PG8_WAIT_V(8); PG8_WAIT_L(0); PG8_BAR; PG8_MMA(1, 0, At, B0); PG8_MMA(1, 1, At, B1); PG8_BAR; PG8_SCHED;
        }
        if (wr == 0) PG8_BAR;
        if constexpr (FP8) asm volatile("s_nop 7\n\ts_nop 7" ::: "memory");
        E(acc, cur, wr, wc, fr, fq); S.done(cur);
        if (!has_next) break;
#pragma unroll
        for (int a = 0; a < 2; ++a)
#pragma unroll
            for (int b = 0; b < 2; ++b)
#pragma unroll
                for (int m = 0; m < 4; ++m)
#pragma unroll
                    for (int n = 0; n < 2; ++n) acc[a][b][m][n] = (f32x4){0.f, 0.f, 0.f, 0.f};
        cur = nxt; cB = nB; ++ui;
        if (wr == 1) PG8_BAR;
    }
    PG8_WAIT_V(0);
    PG8_BAR;
#undef PG8_ROWS
#undef PG8_SA
#undef PG8_SB
#undef PG8_STAGE
#undef PG8_LDA
#undef PG8_LDB
#undef PG8_MMA
#undef PG8_WAIT_V
#undef PG8_WAIT_L
#undef PG8_BAR
#undef PG8_SCHED
}
}

#ifndef MERGE_FP8
#define MERGE_FP8 1
#endif
#ifndef MOE_DN_FP8
#define MOE_DN_FP8 1
#endif
#ifndef MOE_UP_FP8
#define MOE_UP_FP8 1
#endif
#ifndef PROBE_NOATOM
#define PROBE_NOATOM 0
#endif
constexpr int T = 8192, D = 2048, NL = 2, BW = 512, ZC = 14336, INC = 14352;
constexpr int NE = 64, NEX = 65  , ED = 512;
constexpr int BRW = 4 * BW;
constexpr int HK = NEX * ED;
constexpr float ALPHA = 1.41421356237f;
constexpr float LN_EPS = 1e-5f;
constexpr float UPSC = MOE_UP_FP8 ? (1.f / 64.f) : 1.f;
constexpr float BRSC = MERGE_FP8 ? 8.f : 1.f, MGSC = MERGE_FP8 ? (1.f / (8.f * 64.f)) : 1.f;
constexpr float HSC = 8.f, DNSC = MOE_DN_FP8 ? (1.f / (HSC * 64.f)) : 1.f;
constexpr int ZC_SBQ = 0, ZC_SBK = 512, ZC_SBV = 1024, ZC_GMU = 1536, ZC_GMV = 2048, ZC_GDN = 2560, ZC_GDNG = 4096,
              ZC_MLQ = 4608, ZC_MLK = 4864, ZC_MLV = 5120, ZC_MLO = 5632, ZC_GATE = 6144;

#define GAS __attribute__((address_space(1)))
#define LAS __attribute__((address_space(3)))
typedef unsigned short bf16;
typedef unsigned v4u __attribute__((ext_vector_type(4)));
typedef unsigned v2u __attribute__((ext_vector_type(2)));
typedef float v4f __attribute__((ext_vector_type(4)));
typedef float v2f __attribute__((ext_vector_type(2)));
#define LDS_WAIT() asm volatile("s_waitcnt lgkmcnt(0)" ::: "memory")
#define LDS_BAR() do { asm volatile("s_waitcnt lgkmcnt(0)" ::: "memory"); __builtin_amdgcn_s_barrier(); asm volatile("" ::: "memory"); } while (0)

constexpr size_t MiB = 1u << 20;
constexpr size_t WS_CTL = 0, CTL_ZERO_BYTES = 1 * MiB;
constexpr size_t WS_WIN = 2 * MiB, WS_WBR = 58 * MiB, WS_WOUT = 66 * MiB, WS_WUP = 74 * MiB, WS_WDN = 334 * MiB;
constexpr size_t WS_XB = 464 * MiB, WS_SMALL = 496 * MiB, WS_EG = 497 * MiB, WS_BETA = WS_EG + 256 * 1024, WS_COMB = 498 * MiB;
constexpr size_t WS_Z = 500 * MiB, WS_GQ = 724 * MiB, WS_GK = 740 * MiB, WS_GV = 756 * MiB, WS_GO = 772 * MiB, WS_HO = 788 * MiB;
constexpr size_t WS_BR = 804 * MiB, WS_MTMP = 836 * MiB, WS_MSUM = 900 * MiB, WS_Y = 932 * MiB, WS_X1 = 996 * MiB, WS_X1B = 1060 * MiB;
constexpr size_t WS_XCUR = 1092 * MiB, WS_HB = 1156 * MiB, WS_YEXP = 1236 * MiB, WS_LIST = 1524 * MiB, WS_WL = 1526 * MiB, WS_SLOT = 1528 * MiB, WS_MQ = 1530 * MiB, WS_MS = 1534 * MiB, WS_MK = 1538 * MiB, WS_MV = 1542 * MiB, WS_MFL = 1552 * MiB, WS_HDEN = WS_MFL + 65536, WS_VT = 1553 * MiB, WS_END = 1561 * MiB;
constexpr size_t WS_GU = WS_GQ, WS_GNW = WS_GK, WS_GQG = WS_GK + 8 * MiB, WS_GKT = WS_GV, WS_GAT = WS_GV + 8 * MiB, WS_GDL = WS_GV + 12 * MiB;
constexpr int HROWS = 73728;
static_assert(WS_HB + (size_t)HROWS * ED * 2 <= WS_YEXP && WS_YEXP + (size_t)HROWS * D * 2 <= WS_LIST, "ws map (moe)");
static_assert(WS_WIN + (size_t)ZC * D * 2 <= WS_WBR && WS_WUP + (size_t)NEX * 1024 * D * 2 <= WS_WDN && WS_WDN + (size_t)D * HK * 2 <= WS_XB, "ws map (weights)");
static_assert(WS_Z + (size_t)T * ZC * 2 <= WS_GQ, "ws map (acts)");
constexpr int CW_BAR = 4096, CW_CNT = 16384;
constexpr int TAB_OFF = 131072 + 1024;
constexpr int LDS_BYTES = 163840, MISC_OFF = 131072 + 320;

__device__ __forceinline__ float bflo(unsigned w) { return __uint_as_float(w << 16); }
__device__ __forceinline__ float bfhi(unsigned w) { return __uint_as_float(w & 0xffff0000u); }
__device__ __forceinline__ unsigned f2bf(float f) { unsigned u = __float_as_uint(f); return (u + 0x7fffu + ((u >> 16) & 1u)) >> 16; }
__device__ __forceinline__ unsigned pk2(float lo, float hi) { return f2bf(lo) | (f2bf(hi) << 16); }
__device__ __forceinline__ unsigned pk4_f8(float a, float b, float c, float d, float sc) {
    a = __builtin_amdgcn_fmed3f(a * sc, -448.f, 448.f); b = __builtin_amdgcn_fmed3f(b * sc, -448.f, 448.f); c = __builtin_amdgcn_fmed3f(c * sc, -448.f, 448.f); d = __builtin_amdgcn_fmed3f(d * sc, -448.f, 448.f);
    unsigned w = 0; w = __builtin_amdgcn_cvt_pk_fp8_f32(a, b, w, false); w = __builtin_amdgcn_cvt_pk_fp8_f32(c, d, w, true); return w; }
template <int CTRL> __device__ __forceinline__ float dpp(float x) { return __builtin_bit_cast(float, __builtin_amdgcn_mov_dpp(__builtin_bit_cast(int, x), CTRL, 0xf, 0xf, true)); }
__device__ __forceinline__ float sum4(float x) { x += dpp<0xB1>(x); x += dpp<0x4E>(x); return x; }
__device__ __forceinline__ float sum8(float x) { x = sum4(x); x += dpp<0x141>(x); return x; }
__device__ __forceinline__ float sum16(float x) { x = sum8(x); x += dpp<0x140>(x); return x; }
__device__ __forceinline__ float wave_sum(float x) { x = sum16(x); x += __shfl_xor(x, 16); x += __shfl_xor(x, 32); return x; }
__device__ __forceinline__ float max8(float x) { x = fmaxf(x, dpp<0xB1>(x)); x = fmaxf(x, dpp<0x4E>(x)); x = fmaxf(x, dpp<0x141>(x)); return x; }
__device__ __forceinline__ float min8(float x) { x = fminf(x, dpp<0xB1>(x)); x = fminf(x, dpp<0x4E>(x)); x = fminf(x, dpp<0x141>(x)); return x; }
__device__ __forceinline__ float wave_scan_incl(float v) {
    v += __builtin_bit_cast(float, __builtin_amdgcn_update_dpp(0, __builtin_bit_cast(int, v), 0x111, 0xf, 0xf, true));
    v += __builtin_bit_cast(float, __builtin_amdgcn_update_dpp(0, __builtin_bit_cast(int, v), 0x112, 0xf, 0xf, true));
    v += __builtin_bit_cast(float, __builtin_amdgcn_update_dpp(0, __builtin_bit_cast(int, v), 0x114, 0xf, 0xf, true));
    v += __builtin_bit_cast(float, __builtin_amdgcn_update_dpp(0, __builtin_bit_cast(int, v), 0x118, 0xf, 0xf, true));
    v += __builtin_bit_cast(float, __builtin_amdgcn_update_dpp(0, __builtin_bit_cast(int, v), 0x142, 0xa, 0xf, false));
    v += __builtin_bit_cast(float, __builtin_amdgcn_update_dpp(0, __builtin_bit_cast(int, v), 0x143, 0xc, 0xf, false));
    return v;
}
__device__ __forceinline__ float sigmoidf_(float x) { return 1.f / (1.f + __expf(-x)); }
__device__ __forceinline__ float siluf_(float x) { return x / (1.f + __expf(-x)); }
__device__ __forceinline__ float softplusf_(float x) { return fmaxf(x, 0.f) + __logf(1.f + __expf(-fabsf(x))); }
__device__ __forceinline__ float gelu_tanh(float x) { const float y = 0.7978845608f * (x + 0.044715f * x * x * x); const float t = 1.f - 2.f / (__expf(2.f * y) + 1.f); return 0.5f * x * (1.f + t); }
__device__ __forceinline__ void unpack8(const v4u r, float (&f)[8]) { f[0] = bflo(r.x); f[1] = bfhi(r.x); f[2] = bflo(r.y); f[3] = bfhi(r.y); f[4] = bflo(r.z); f[5] = bfhi(r.z); f[6] = bflo(r.w); f[7] = bfhi(r.w); }
#define XB_TMO      128
#define XB_XCNT(j)  (256  + 64 * (j))
#define XB_XSUB(j)  (1280 + 64 * (j))
#define XB_XGEN(j)  (2304 + 64 * (j))
#define XB_TOP      3328
#define XB_TOPGEN   3392
#define XCD_BAR_WORDS 3456
#define XB_SPIN_CAP (1u << 18)

__device__ __forceinline__ unsigned xb_ld(unsigned* p)              { return __hip_atomic_load(p, __ATOMIC_RELAXED, __HIP_MEMORY_SCOPE_AGENT); }
__device__ __forceinline__ unsigned xb_add(unsigned* p, unsigned v) { return __hip_atomic_fetch_add(p, v, __ATOMIC_RELAXED, __HIP_MEMORY_SCOPE_AGENT); }
__device__ __forceinline__ unsigned xb_xcc_id() { return (unsigned)__builtin_amdgcn_s_getreg((3 << 11) | 20) & 0xFu; }
#define XB_SPIN(cond, bar) do { unsigned _sp = 0; while (cond) { __builtin_amdgcn_s_sleep(1); \
    if ((++_sp & 255u) == 0u) { if (xb_ld(&(bar)[XB_TMO])) break; if (_sp > XB_SPIN_CAP) { atomicAdd(&(bar)[XB_TMO], 1u); break; } } } } while (0)

struct XcdBarrier {
    unsigned* bar; unsigned x;
    volatile LAS unsigned* st;
};

__device__ __forceinline__ XcdBarrier xcd_barrier_post(unsigned* bar, volatile LAS unsigned* st) {
    XcdBarrier b; b.bar = bar; b.x = xb_xcc_id(); b.st = st;
    if (threadIdx.x == 0) (void)xb_add(&bar[XB_XCNT(b.x)], 1u);
    return b;
}
__device__ __forceinline__ void xcd_barrier_complete(unsigned* bar, unsigned x, unsigned& nloc, unsigned& nx) {
    const unsigned G = gridDim.x * gridDim.y * gridDim.z;
    unsigned sum, cnt, mine, sp = 0u;
    for (;;) {
        sum = 0u; cnt = 0u; mine = 0u;
#pragma unroll
        for (unsigned j = 0; j < 16; ++j) { const unsigned c = xb_ld(&bar[XB_XCNT(j)]); sum += c; cnt += (c > 0u) ? 1u : 0u; mine = (j == x) ? c : mine; }
        if (sum == G) break;
        __builtin_amdgcn_s_sleep(1);
        if ((++sp & 255u) == 0u) { if (xb_ld(&bar[XB_TMO])) break; if (sp > XB_SPIN_CAP) { atomicAdd(&bar[XB_TMO], 1u); break; } }
    }
    nloc = mine > 0u ? mine : 1u; nx = cnt > 0u ? cnt : 1u;
}

__device__ __forceinline__ void xcd_barrier(const XcdBarrier& b) {
    asm volatile("s_waitcnt vmcnt(0)" ::: "memory");
    __syncthreads();
    if (threadIdx.x == 0) {
        unsigned* bar = b.bar;
        __builtin_amdgcn_s_waitcnt(0);
        unsigned nloc = b.st[0], nx = b.st[1];
        if (nloc == 0u) { xcd_barrier_complete(bar, b.x, nloc, nx); b.st[0] = nloc; b.st[1] = nx; }
        const unsigned old = xb_add(&bar[XB_XSUB(b.x)], 1u);
        const unsigned gen = old / nloc;
        if (old + 1u == (gen + 1u) * nloc) {
            __builtin_amdgcn_fence(__ATOMIC_RELEASE, "agent");
            asm volatile("s_waitcnt vmcnt(0)" ::: "memory");
            const unsigned og = xb_add(&bar[XB_TOP], 1u);
            const unsigned tg = og / nx;
            if (og + 1u == (tg + 1u) * nx) xb_add(&bar[XB_TOPGEN], 1u);
            else XB_SPIN(xb_ld(&bar[XB_TOPGEN]) == tg, bar);
            __builtin_amdgcn_fence(__ATOMIC_ACQUIRE, "agent");
            xb_add(&bar[XB_XGEN(b.x)], 1u);
            asm volatile("s_waitcnt vmcnt(0)" ::: "memory");
        } else {
            XB_SPIN(xb_ld(&bar[XB_XGEN(b.x)]) == gen, bar);
            __builtin_amdgcn_fence(__ATOMIC_ACQUIRE, "agent");
            asm volatile("s_waitcnt vmcnt(0)" ::: "memory");
        }
    }
    __syncthreads();
}

struct Params { const float* in[27]; float* out; unsigned char* ws; int ph_lo, ph_hi; };
enum { I_X = 0, I_WIN, I_GMNG, I_GMNB, I_GMWS, I_GMBS, I_CONVW, I_ALOG, I_DTB, I_GDNNG, I_MLIB, I_MLFB, I_MLNG, I_WBR, I_WOUT, I_LN1G, I_LN1B,
       I_WR, I_RB, I_WG, I_WU, I_WD, I_SG, I_SU, I_SD, I_LN2G, I_LN2B };

using pg8::f32x4; using pg8::u32x4; using pg8::Unit; using pg8::HALF; using pg8::BM;

struct EpiMergeH {
    static constexpr bool PERM = true, AFTER_DRAIN = false; static constexpr int MID = MERGE_FP8 ? BW / (2 * pg8::BK) : BW / pg8::BK;
    const bf16* Z; bf16* msum;
    __device__ __forceinline__ void mid(f32x4 (&acc)[2][2][4][2], const Unit& u, int j, int wr, int wc, int fr, int fq) const {
        int row0 = u.pm * BM + wr * 64 + fr; const int col0 = u.pn * BM + wc * 32 + 8 * fq; asm volatile("" : "+v"(row0));
        const bf16* zp = Z + ZC_GATE + (size_t)(j - 1) * D + col0;
#pragma unroll
        for (int am = 0; am < 4; ++am) { const int ai = am >> 1, m0 = (am & 1) * 2; v4u ga[2][2], gb[2][2];
#pragma unroll
            for (int m = 0; m < 2; ++m)
#pragma unroll
                for (int bj = 0; bj < 2; ++bj) { const bf16* q = zp + (size_t)(row0 + ai * HALF + (m0 + m) * 16) * ZC + bj * HALF; ga[m][bj] = *(const v4u*)q; gb[m][bj] = *(const v4u*)(q + D); }
#pragma unroll
            for (int m = 0; m < 2; ++m)
#pragma unroll
                for (int bj = 0; bj < 2; ++bj) { float a[8], b[8]; unpack8(ga[m][bj], a); unpack8(gb[m][bj], b);
#pragma unroll
                    for (int i = 0; i < 8; ++i) { const float ea = __builtin_amdgcn_exp2f(fmaxf(a[i], -60.f) * -1.44269504f), eb = __builtin_amdgcn_exp2f(fmaxf(b[i], -60.f) * -1.44269504f);
                        acc[ai][bj][m0 + m][i >> 2][i & 3] *= (1.f + eb) * __builtin_amdgcn_rcpf(1.f + ea); } }
            asm volatile("" ::: "memory"); }
    }
    __device__ __forceinline__ void operator()(const f32x4 (&acc)[2][2][4][2], const Unit& u, int wr, int wc, int fr, int fq) const {
        const int row0 = u.pm * BM + wr * 64 + fr, col0 = u.pn * BM + wc * 32 + 8 * fq;
#pragma unroll
        for (int ai = 0; ai < 2; ++ai) { v4u gg[4][2];
#pragma unroll
            for (int m = 0; m < 4; ++m)
#pragma unroll
                for (int bj = 0; bj < 2; ++bj) gg[m][bj] = *(const v4u*)(Z + (size_t)(row0 + ai * HALF + m * 16) * ZC + ZC_GATE + 3 * D + col0 + bj * HALF);
#pragma unroll
            for (int m = 0; m < 4; ++m)
#pragma unroll
                for (int bj = 0; bj < 2; ++bj) { const size_t row = (size_t)(row0 + ai * HALF + m * 16); const int col = col0 + bj * HALF; float gl[8]; unpack8(gg[m][bj], gl);
                    f32x4 v0 = acc[ai][bj][m][0], v1 = acc[ai][bj][m][1];
#pragma unroll
                    for (int j = 0; j < 4; ++j) { v0[j] *= sigmoidf_(gl[j]) * MGSC; v1[j] *= sigmoidf_(gl[4 + j]) * MGSC; }
                    unsigned w0 = 0, w1 = 0; w0 = __builtin_amdgcn_cvt_pk_fp8_f32(v0[0], v0[1], w0, false); w0 = __builtin_amdgcn_cvt_pk_fp8_f32(v0[2], v0[3], w0, true); w1 = __builtin_amdgcn_cvt_pk_fp8_f32(v1[0], v1[1], w1, false); w1 = __builtin_amdgcn_cvt_pk_fp8_f32(v1[2], v1[3], w1, true);
                    *(v2u*)((unsigned char*)msum + row * D + col) = (v2u){w0, w1}; }
            asm volatile("" ::: "memory"); }
    }
};
struct EpiResid {
    static constexpr bool PERM = false, AFTER_DRAIN = false; static constexpr int MID = 0;
    const float* X; float* Y; float sc;
    __device__ __forceinline__ void operator()(const f32x4 (&acc)[2][2][4][2], const Unit& u, int wr, int wc, int fr, int fq) const {
        const int row0 = u.pm * BM + wr * 64 + fr, col0 = u.pn * BM + wc * 32 + 4 * fq;
#pragma unroll
        for (int ai = 0; ai < 2; ++ai)
#pragma unroll
            for (int m = 0; m < 4; ++m) { const size_t off = (size_t)(row0 + ai * HALF + m * 16) * D + col0;
#pragma unroll
                for (int bj = 0; bj < 2; ++bj)
#pragma unroll
                    for (int n = 0; n < 2; ++n) { const f32x4 xv = *(const f32x4*)(X + off + bj * HALF + n * 16); *(f32x4*)(Y + off + bj * HALF + n * 16) = xv * ALPHA + acc[ai][bj][m][n] * sc; } }
    }
};
struct MoeTab {
    LAS int* t; LAS unsigned short* tok; LAS float* wt; LAS unsigned char* mte;
    __device__ __forceinline__ MoeTab(LAS unsigned char* lds) : t((LAS int*)(lds + TAB_OFF)), tok((LAS unsigned short*)(lds + TAB_OFF + 1024)), wt((LAS float*)(lds + TAB_OFF + 5120)), mte((LAS unsigned char*)(lds + TAB_OFF + 13312)) {}
};
__device__ __forceinline__ void moe_tables(const MoeTab& M, const unsigned* cnt  , int tid, int lane, int wave) {
    __syncthreads();
    if (wave == 0) { const int c = (int)cnt[64 * lane]; const int tiles = (c + 255) >> 8; const float incl = wave_scan_incl((float)tiles);
        M.t[80 + lane] = c; M.t[lane] = (int)incl - tiles; if (lane == 63) { M.t[64] = (int)incl; M.t[65] = (int)incl + T / 256; M.t[80 + 64] = T; } }
    __syncthreads();
    const int Mt = M.t[65];
    for (int mt = tid; mt < Mt; mt += 512) { int e = 0;
        for (int k = 1; k <= 64; ++k) e = (M.t[k] <= mt) ? k : e;
        M.mte[mt] = (unsigned char)e; }
    __syncthreads();
}
struct UpOrder {
    MoeTab M; int n;
    __device__ __forceinline__ bool next(int i, Unit& u) const { if (i >= n) return false; u.pm = M.t[168 + i]; u.pn = M.t[176 + i]; u.aux = i; return true; }
    __device__ __forceinline__ int row_token(int i, int r) const { return (int)M.tok[i * 256 + r]; }
    __device__ __forceinline__ void a_ready(const Unit&) const {}
    __device__ __forceinline__ void done(const Unit&) const {}
};
__device__ __forceinline__ int up_order_build(const MoeTab& M, const int* LIST, const float* WL, int wg, int G, int tid) {
    const int U = 4 * M.t[65];
    if (tid < 8) { const int L = tid * G + wg; if (L < U) { const int mt = L >> 2, q = L & 3, e = M.mte[mt]; M.t[168 + tid] = mt; M.t[176 + tid] = e * 4 + q; M.t[184 + tid] = e; M.t[192 + tid] = mt - M.t[e]; } }
    int n = 0;
#pragma unroll
    for (int i = 0; i < 8; ++i) n += (i * G + wg < U) ? 1 : 0;
    __syncthreads();
    for (int idx = tid; idx < n * 256; idx += 512) { const int i = idx >> 8, r = idx & 255, e = M.t[184 + i], li = M.t[192 + i] * 256 + r;
        int tk = 0; float w = 0.f;
        if (e < NE) { if (li < M.t[80 + e]) { tk = LIST[e * T + li]; w = WL[e * T + li]; } } else { tk = li; w = 1.f; }
        M.tok[idx] = (unsigned short)tk; M.wt[idx] = w; }
    __syncthreads();
    return n;
}
struct EpiGluSparse {
    static constexpr bool PERM = true, AFTER_DRAIN = false; static constexpr int MID = 0;
    LAS const float* wt; bf16* H;
    __device__ __forceinline__ void operator()(const f32x4 (&acc)[2][2][4][2], const Unit& u, int wr, int wc, int fr, int fq) const {
        const int q = u.pn & 3; const int rl0 = wr * 64 + fr, col0 = q * 128 + wc * 32 + 8 * fq;
#pragma unroll
        for (int ai = 0; ai < 2; ++ai)
#pragma unroll
            for (int m = 0; m < 4; ++m) { const int rl = rl0 + ai * HALF + m * 16; const float c = wt[u.aux * 256 + rl]; float h[8];
#pragma unroll
                for (int n = 0; n < 2; ++n)
#pragma unroll
                    for (int j = 0; j < 4; ++j) h[4 * n + j] = siluf_(acc[ai][0][m][n][j] * UPSC) * (acc[ai][1][m][n][j] * UPSC) * c;
#if MOE_DN_FP8
#pragma unroll
                for (int j = 0; j < 8; ++j) h[j] = __builtin_amdgcn_fmed3f(h[j] * HSC, -448.f, 448.f);
                unsigned w0 = 0, w1 = 0; w0 = __builtin_amdgcn_cvt_pk_fp8_f32(h[0], h[1], w0, false); w0 = __builtin_amdgcn_cvt_pk_fp8_f32(h[2], h[3], w0, true); w1 = __builtin_amdgcn_cvt_pk_fp8_f32(h[4], h[5], w1, false); w1 = __builtin_amdgcn_cvt_pk_fp8_f32(h[6], h[7], w1, true);
                *(v2u*)((unsigned char*)H + ((size_t)u.pm * 256 + rl) * ED + col0) = (v2u){w0, w1}; }
#else
                u32x4 w; w.x = pk2(h[0], h[1]); w.y = pk2(h[2], h[3]); w.z = pk2(h[4], h[5]); w.w = pk2(h[6], h[7]);
                *(u32x4*)(H + ((size_t)u.pm * 256 + rl) * ED + col0) = w; }
#endif
    }
};
struct DownOrder {
    MoeTab M; int G, c, U;
    __device__ __forceinline__ bool next(int i, Unit& u) const { const int L = i * G + c; if (L >= U) return false; const int mt = L >> 3; u.pm = mt; u.pn = (int)M.mte[mt] * 8 + (L & 7); u.aux = 0; return true; }
    __device__ __forceinline__ void a_ready(const Unit&) const {}
    __device__ __forceinline__ void done(const Unit&) const {}
};
struct EpiYexp {
    static constexpr bool PERM = true, AFTER_DRAIN = false; static constexpr int MID = 0;
    bf16* Y;
    __device__ __forceinline__ void operator()(const f32x4 (&acc)[2][2][4][2], const Unit& u, int wr, int wc, int fr, int fq) const {
        const int row0 = u.pm * BM + wr * 64 + fr, col0 = (u.pn & 7) * BM + wc * 32 + 8 * fq;
#pragma unroll
        for (int ai = 0; ai < 2; ++ai)
#pragma unroll
            for (int m = 0; m < 4; ++m) { bf16* rowp = Y + (size_t)(row0 + ai * HALF + m * 16) * D + col0;
#pragma unroll
                for (int bj = 0; bj < 2; ++bj) { const f32x4 v0 = acc[ai][bj][m][0] * DNSC, v1 = acc[ai][bj][m][1] * DNSC;
                    u32x4 w; w.x = pk2(v0[0], v0[1]); w.y = pk2(v0[2], v0[3]); w.z = pk2(v1[0], v1[1]); w.w = pk2(v1[2], v1[3]); *(u32x4*)(rowp + bj * HALF) = w; } }
    }
};

struct TrItem { const float* src; bf16* dst; unsigned sld, dld; int f8; };
__device__ __forceinline__ void tr_load(const TrItem& t, int lane, v4f (&v)[8]) { const int r8 = lane >> 3, c4 = lane & 7;
#pragma unroll
    for (int i = 0; i < 8; ++i) v[i] = *(const v4f*)(t.src + (size_t)(8 * i + r8) * t.sld + 4 * c4); }
__device__ __forceinline__ void tr_store(const TrItem& t, const v4f (&v)[8], LAS float* scr, int lane, bool nostore = false) {
    { const int r8 = lane >> 3, c4 = lane & 7;
#pragma unroll
      for (int i = 0; i < 8; ++i) { LAS float* d = scr + (8 * i + r8) * 33 + 4 * c4; d[0] = v[i].x; d[1] = v[i].y; d[2] = v[i].z; d[3] = v[i].w; } }
    LDS_WAIT(); asm volatile("" ::: "memory");
    if (nostore) return;
    if (t.f8) {
        const int c = lane & 3;
#pragma unroll
        for (int j = 0; j < 2; ++j) { const int n = (lane >> 2) + 16 * j; const LAS float* s = scr + (16 * c) * 33 + n; unsigned w[4];
#pragma unroll
            for (int q = 0; q < 4; ++q) { unsigned x = 0; x = __builtin_amdgcn_cvt_pk_fp8_f32(s[(4 * q) * 33] * 64.f, s[(4 * q + 1) * 33] * 64.f, x, false); x = __builtin_amdgcn_cvt_pk_fp8_f32(s[(4 * q + 2) * 33] * 64.f, s[(4 * q + 3) * 33] * 64.f, x, true); w[q] = x; }
            *(v4u*)((unsigned char*)t.dst + (size_t)n * t.dld + 16 * c) = (v4u){w[0], w[1], w[2], w[3]}; }
    } else {
        const int c = lane & 7;
#pragma unroll
        for (int j = 0; j < 4; ++j) { const int n = (lane >> 3) + 8 * j; const LAS float* s = scr + (8 * c) * 33 + n;
            v4u o; o.x = pk2(s[0 * 33], s[1 * 33]); o.y = pk2(s[2 * 33], s[3 * 33]); o.z = pk2(s[4 * 33], s[5 * 33]); o.w = pk2(s[6 * 33], s[7 * 33]);
            *(v4u*)(t.dst + (size_t)n * t.dld + 8 * c) = o; }
    }
    LDS_WAIT(); asm volatile("" ::: "memory");
}
template <int PART> __device__ __forceinline__ TrItem tr_decode(const Params& p, int l, int it) {
    unsigned char* ws = p.ws;
    constexpr int N_IN = (ZC / 32) * (D / 64), N_BR = 4 * (BW / 64) * (D / 32), N_OUT = (D / 64) * (D / 32), N_UP = NEX * 2 * (D / 64) * (ED / 32);
    int r = it; TrItem t; t.f8 = 0;
    if (PART == 0) {
        const float* w_in = p.in[I_WIN] + (size_t)l * D * INC; const float* w_br = p.in[I_WBR] + (size_t)l * 4 * BW * D; const float* w_out = p.in[I_WOUT] + (size_t)l * D * D;
        bf16* WIN = (bf16*)(ws + WS_WIN); bf16* WBR = (bf16*)(ws + WS_WBR); bf16* WOUT = (bf16*)(ws + WS_WOUT);
        if (r < N_IN) { const int kb = r / (ZC / 32), n0 = (r % (ZC / 32)) * 32, k0 = kb * 64; const int sc = n0 + (n0 >= ZC_GATE ? 16 : (n0 >= ZC_MLQ ? 8 : 0));
            t.src = w_in + (size_t)k0 * INC + sc; t.sld = INC; t.dst = (bf16*)((unsigned char*)WIN + (size_t)n0 * D + k0); t.dld = D; t.f8 = 1; return t; } r -= N_IN;
        if (r < N_BR) { const int g = r / 512, rr = r % 512, k0 = (rr / 64) * 64, n0 = (rr % 64) * 32;
            t.src = w_br + ((size_t)g * BW + k0) * D + n0; t.sld = D;
#if MERGE_FP8
            t.dst = (bf16*)((unsigned char*)WBR + (size_t)n0 * BRW + g * BW + k0); t.dld = BRW; t.f8 = 1; return t; }
#else
            t.dst = WBR + (size_t)n0 * BRW + g * BW + k0; t.dld = BRW; return t; }
#endif
        r -= N_BR;
        { const int k0 = (r / 64) * 64, n0 = (r % 64) * 32; t.src = w_out + (size_t)k0 * D + n0; t.sld = D; t.dst = (bf16*)((unsigned char*)WOUT + (size_t)n0 * D + k0); t.dld = D; t.f8 = 1; return t; }
    } else {
        const float* w_g = p.in[I_WG] + (size_t)l * NE * D * ED; const float* w_u = p.in[I_WU] + (size_t)l * NE * D * ED; const float* w_d = p.in[I_WD] + (size_t)l * NE * ED * D;
        const float* s_g = p.in[I_SG] + (size_t)l * D * ED; const float* s_u = p.in[I_SU] + (size_t)l * D * ED; const float* s_d = p.in[I_SD] + (size_t)l * ED * D;
        bf16* WUP = (bf16*)(ws + WS_WUP); bf16* WDN = (bf16*)(ws + WS_WDN);
        if (r < N_UP) { const int e = r / 1024, rr = r % 1024, mat = rr / 512, r2 = rr % 512, k0 = (r2 / 16) * 64, n0 = (r2 % 16) * 32;
            const float* sb = (e < NE) ? ((mat ? w_u : w_g) + (size_t)e * D * ED) : (mat ? s_u : s_g);
            const int drow = e * 1024 + (n0 / 128) * 256 + mat * 128 + (n0 % 128);
            t.src = sb + (size_t)k0 * ED + n0; t.sld = ED;
#if MOE_UP_FP8
            t.dst = (bf16*)((unsigned char*)WUP + (size_t)drow * D + k0); t.dld = D; t.f8 = 1; return t; }
#else
            t.dst = WUP + (size_t)drow * D + k0; t.dld = D; return t; }
#endif
        r -= N_UP;
        { const int e = r / 512, rr = r % 512, k0 = (rr / 64) * 64, n0 = (rr % 64) * 32;
            const float* sb = (e < NE) ? (w_d + (size_t)e * ED * D) : s_d;
            t.src = sb + (size_t)k0 * D + n0; t.sld = D;
#if MOE_DN_FP8
            t.dst = (bf16*)((unsigned char*)WDN + ((size_t)e * D + n0) * ED + k0); t.dld = ED; t.f8 = 1; return t; }
#else
            t.dst = WDN + ((size_t)e * D + n0) * ED + k0; t.dld = ED; return t; }
#endif
    }
}
template <int PART> __device__ __forceinline__ void phase_convert(const Params& p, int l, LAS unsigned char* lds, int gw, int NGW, int wave, int lane, bool nostore = false) {
    constexpr int N_IN = (ZC / 32) * (D / 64), N_BR = 4 * (BW / 64) * (D / 32), N_OUT = (D / 64) * (D / 32), N_UP = NEX * 2 * (D / 64) * (ED / 32), N_DN = NEX * (ED / 64) * (D / 32);
    constexpr int NITEMS = (PART == 0) ? (N_IN + N_BR + N_OUT) : (N_UP + N_DN);
    LAS float* scr = (LAS float*)(lds + wave * 16384);
    if (gw >= NITEMS) return;
    TrItem cur = tr_decode<PART>(p, l, gw); v4f va[8], vb[8];
    tr_load(cur, lane, va);
    for (int it = gw; it < NITEMS; it += 2 * NGW) {
        const int i1 = it + NGW, i2 = it + 2 * NGW; TrItem nx = cur;
        if (i1 < NITEMS) { nx = tr_decode<PART>(p, l, i1); } tr_load(nx, lane, vb);
        tr_store(cur, va, scr, lane, nostore);
        if (i1 >= NITEMS) break;
        cur = nx; if (i2 < NITEMS) { cur = tr_decode<PART>(p, l, i2); } tr_load(cur, lane, va);
        tr_store(nx, vb, scr, lane, nostore);
        if (i2 >= NITEMS) break;
    }
}
__device__ __forceinline__ void phase_xprep(const Params& p, int l, const float* xin, LAS unsigned char* lds, int gw, int NGW, int tid, int lane) {
    const float* w_in = p.in[I_WIN] + (size_t)l * D * INC;
    constexpr int XP = 2052; LAS float* xt = (LAS float*)lds; LAS float* part = (LAS float*)lds;
    const int wave = tid >> 6, n_l = lane & 15, kq = lane >> 4, wg = gw >> 3, G = NGW >> 3;
    const int colw = n_l < 8 ? 4608 + n_l : 6152 + (n_l - 8);
    float bw[64];
#pragma unroll
    for (int q = 0; q < 64; ++q) bw[q] = w_in[(size_t)(256 * wave + 16 * (q >> 2) + 4 * kq + (q & 3)) * INC + colw];
    unsigned char* XB = p.ws + WS_XB; float* SMALL = (float*)(p.ws + WS_SMALL);
    __syncthreads();
    for (int tg = wg; tg < T / 16; tg += G) {
        {   v4f va[8], vb[8]; const size_t m0 = (size_t)tg * 16 + 2 * wave;
            const v4f* xa = (const v4f*)(xin + m0 * D) + lane; const v4f* xb = (const v4f*)(xin + (m0 + 1) * D) + lane;
#pragma unroll
            for (int j = 0; j < 8; ++j) { va[j] = xa[64 * j]; vb[j] = xb[64 * j]; }
#pragma unroll
            for (int rr = 0; rr < 2; ++rr) { unsigned* xo = (unsigned*)(XB + (m0 + rr) * D) + lane;
#pragma unroll
                for (int j = 0; j < 8; ++j) { const v4f v = rr ? vb[j] : va[j]; unsigned w = 0; w = __builtin_amdgcn_cvt_pk_fp8_f32(v.x, v.y, w, false); w = __builtin_amdgcn_cvt_pk_fp8_f32(v.z, v.w, w, true); xo[64 * j] = w;
                    *(LAS v4f*)(xt + (2 * wave + rr) * XP + 4 * lane + 256 * j) = v; } } }
        __syncthreads();
        {   pg8::f32x4 acc[4];
#pragma unroll
            for (int i = 0; i < 4; ++i) acc[i] = (pg8::f32x4){0.f, 0.f, 0.f, 0.f};
            const LAS float* xa = xt + n_l * XP + 256 * wave + 4 * kq;
#pragma unroll
            for (int s2 = 0; s2 < 16; ++s2) { const v4f a4 = *(const LAS v4f*)(xa + 16 * s2);
                acc[0] = __builtin_amdgcn_mfma_f32_16x16x4f32(a4.x, bw[4 * s2 + 0], acc[0], 0, 0, 0); acc[1] = __builtin_amdgcn_mfma_f32_16x16x4f32(a4.y, bw[4 * s2 + 1], acc[1], 0, 0, 0);
                acc[2] = __builtin_amdgcn_mfma_f32_16x16x4f32(a4.z, bw[4 * s2 + 2], acc[2], 0, 0, 0); acc[3] = __builtin_amdgcn_mfma_f32_16x16x4f32(a4.w, bw[4 * s2 + 3], acc[3], 0, 0, 0); }
            const pg8::f32x4 tot = (acc[0] + acc[1]) + (acc[2] + acc[3]);
            __syncthreads();
#pragma unroll
            for (int j = 0; j < 4; ++j) part[(wave * 16 + 4 * kq + j) * 16 + n_l] = tot[j]; }
        __syncthreads();
        if (tid < 256) { float a = 0.f;
#pragma unroll
            for (int w = 0; w < 8; ++w) a += part[w * 256 + tid];
            SMALL[(size_t)tg * 256 + tid] = a; }
        __syncthreads();
    }
}


typedef short bf16x8_t __attribute__((ext_vector_type(8)));
__device__ __forceinline__ void ml_pre_item(const Params& p, int l, LAS unsigned char* lds, int item, int tid, int wave, int lane) {
    const int h = item & 3, n = item >> 2; const size_t t0 = (size_t)n * 64;
    const bf16* Z = (const bf16*)(p.ws + WS_Z); const float* SMALL = (const float*)(p.ws + WS_SMALL);
    bf16* MQ = (bf16*)(p.ws + WS_MQ) + (size_t)item * 4096; bf16* MS = (bf16*)(p.ws + WS_MS) + (size_t)item * 4096; bf16* MK = (bf16*)(p.ws + WS_MK) + (size_t)item * 4096;
    bf16* MV = (bf16*)(p.ws + WS_MV) + (size_t)item * 9216; float* MFL = (float*)(p.ws + WS_MFL);
    LAS float* qs = (LAS float*)lds;
    LAS float* ks = qs + 64 * 65;
    LAS float* bs = ks + 64 * 65;
    LAS unsigned short* vs = (LAS unsigned short*)(bs + 128);
    { const int tk = tid >> 3, c8 = tid & 7; float f[8];
      unpack8(*(const v4u*)(Z + (t0 + tk) * ZC + ZC_MLQ + h * 64 + 8 * c8), f);
#pragma unroll
      for (int i = 0; i < 8; ++i) qs[tk * 65 + 8 * c8 + i] = f[i];
      unpack8(*(const v4u*)(Z + (t0 + tk) * ZC + ZC_MLK + h * 64 + 8 * c8), f);
#pragma unroll
      for (int i = 0; i < 8; ++i) ks[tk * 65 + 8 * c8 + i] = f[i]; }
#pragma unroll
    for (int r = 0; r < 2; ++r) { const int idx = tid + 512 * r, tk = idx >> 4, c8 = idx & 15;
        *(LAS v4u*)(vs + tk * 136 + 8 * c8) = *(const v4u*)(Z + (t0 + tk) * ZC + ZC_MLV + h * 128 + 8 * c8); }
    if (wave == 0) { const float fp = SMALL[(t0 + lane) * 16 + 12 + h] + p.in[I_MLFB][l * 4 + h]; const float lf = -softplusf_(-fp);
        bs[lane] = wave_scan_incl(lf); bs[64 + lane] = SMALL[(t0 + lane) * 16 + 8 + h] + p.in[I_MLIB][l * 4 + h]; }
    __syncthreads();
    const float blast = bs[63];
    { const int i = tid >> 3, jb = tid & 7; const float bi = bs[i];
      { const float e = __expf(bi) * 0.125f; float o[8];
#pragma unroll
        for (int x = 0; x < 8; ++x) o[x] = qs[i * 65 + 8 * jb + x] * e;
        v4u w; w.x = pk2(o[0], o[1]); w.y = pk2(o[2], o[3]); w.z = pk2(o[4], o[5]); w.w = pk2(o[6], o[7]); *(v4u*)(MQ + i * 64 + 8 * jb) = w; }
      { float d[8];
#pragma unroll
        for (int x = 0; x < 8; ++x) d[x] = 0.f;
        if (8 * jb <= i) {
            for (int dd = 0; dd < 64; ++dd) { const float qv = qs[i * 65 + dd];
#pragma unroll
                for (int x = 0; x < 8; ++x) d[x] += qv * ks[(8 * jb + x) * 65 + dd]; }
#pragma unroll
            for (int x = 0; x < 8; ++x) { const int j = 8 * jb + x; d[x] = (j <= i) ? __expf(bi - bs[j] + bs[64 + j]) * d[x] * 0.125f : 0.f; } }
        v4u w; w.x = pk2(d[0], d[1]); w.y = pk2(d[2], d[3]); w.z = pk2(d[4], d[5]); w.w = pk2(d[6], d[7]); *(v4u*)(MS + i * 64 + 8 * jb) = w; }
      { float o[8];
#pragma unroll
        for (int x = 0; x < 8; ++x) { const int j = 8 * jb + x; o[x] = ks[j * 65 + i] * __expf(blast - bs[j] + bs[64 + j]); }
        v4u w; w.x = pk2(o[0], o[1]); w.y = pk2(o[2], o[3]); w.z = pk2(o[4], o[5]); w.w = pk2(o[6], o[7]); *(v4u*)(MK + i * 64 + 8 * jb) = w; }
    }
    { const int c = tid >> 2, jq = tid & 3; unsigned w[8];
#pragma unroll
      for (int x = 0; x < 8; ++x) w[x] = (unsigned)vs[(16 * jq + 2 * x) * 136 + c] | ((unsigned)vs[(16 * jq + 2 * x + 1) * 136 + c] << 16);
      *(v4u*)(MV + c * 64 + 16 * jq) = (v4u){w[0], w[1], w[2], w[3]}; *(v4u*)(MV + c * 64 + 16 * jq + 8) = (v4u){w[4], w[5], w[6], w[7]};
      if (tid < 64) { const int c2 = 128 + (tid >> 2); const unsigned one = (c2 == 128) ? 0x3F803F80u : 0u;
          *(v4u*)(MV + c2 * 64 + 16 * jq) = (v4u){one, one, one, one}; *(v4u*)(MV + c2 * 64 + 16 * jq + 8) = (v4u){one, one, one, one}; } }
    if (tid == 0) MFL[item] = __expf(blast);
    __syncthreads();
}
struct MlFrags { bf16x8_t q[2], s[2], kt[2], vt[2]; float fl; };
__device__ __forceinline__ void ml_load(MlFrags& F, const Params& p, int item, int offA, int offV) {
    const bf16* MQ = (const bf16*)(p.ws + WS_MQ) + (size_t)item * 4096; const bf16* MS = (const bf16*)(p.ws + WS_MS) + (size_t)item * 4096; const bf16* MK = (const bf16*)(p.ws + WS_MK) + (size_t)item * 4096;
    const bf16* MV = (const bf16*)(p.ws + WS_MV) + (size_t)item * 9216;
#pragma unroll
    for (int ks = 0; ks < 2; ++ks) { F.q[ks] = *(const bf16x8_t*)(MQ + offA + 32 * ks); F.s[ks] = *(const bf16x8_t*)(MS + offA + 32 * ks); F.kt[ks] = *(const bf16x8_t*)(MK + offA + 32 * ks); F.vt[ks] = *(const bf16x8_t*)(MV + offV + 32 * ks); }
    F.fl = ((const float*)(p.ws + WS_MFL))[item];
}
__device__ __forceinline__ void ml_seq(const Params& p, LAS unsigned char* lds, int wgi, int wave, int lane) {
    const int u = wgi * 2 + (wave >> 2), wi = wave & 3, h = u / 9, sl = u % 9, g = lane >> 4, c = lane & 15;
    LAS unsigned short* CT = (LAS unsigned short*)(lds + (wave >> 2) * 4096);
    float* HO = (float*)(p.ws + WS_HO); float* HDEN = (float*)(p.ws + WS_HDEN);
    const int offA = (16 * wi + c) * 64 + 8 * g, offV = (16 * sl + c) * 64 + 8 * g;
    *(LAS v2u*)(CT + c * 64 + 16 * wi + 4 * g) = (v2u){0u, 0u};
    pg8::f32x4 Cacc = {0.f, 0.f, 0.f, 0.f};
    __syncthreads();
    MlFrags F0, F1;
    ml_load(F0, p, h, offA, offV);
#define ML_STEP(F, n_) do { const int cur = (n_) & 1; \
        const bf16x8_t c0 = *(const LAS bf16x8_t*)(CT + cur * 1024 + c * 64 + 8 * g), c1 = *(const LAS bf16x8_t*)(CT + cur * 1024 + c * 64 + 32 + 8 * g); \
        pg8::f32x4 num = {0.f, 0.f, 0.f, 0.f}; \
        num = __builtin_amdgcn_mfma_f32_16x16x32_bf16(F.q[0], c0, num, 0, 0, 0); num = __builtin_amdgcn_mfma_f32_16x16x32_bf16(F.q[1], c1, num, 0, 0, 0); \
        num = __builtin_amdgcn_mfma_f32_16x16x32_bf16(F.s[0], F.vt[0], num, 0, 0, 0); num = __builtin_amdgcn_mfma_f32_16x16x32_bf16(F.s[1], F.vt[1], num, 0, 0, 0); \
        Cacc = Cacc * F.fl; \
        Cacc = __builtin_amdgcn_mfma_f32_16x16x32_bf16(F.kt[0], F.vt[0], Cacc, 0, 0, 0); Cacc = __builtin_amdgcn_mfma_f32_16x16x32_bf16(F.kt[1], F.vt[1], Cacc, 0, 0, 0); \
        { v2u w; w.x = pk2(Cacc[0], Cacc[1]); w.y = pk2(Cacc[2], Cacc[3]); *(LAS v2u*)(CT + (cur ^ 1) * 1024 + c * 64 + 16 * wi + 4 * g) = w; } \
        { const size_t tb = (size_t)(n_) * 64 + 16 * wi + 4 * g; \
          if (sl < 8) { _Pragma("unroll") for (int r = 0; r < 4; ++r) HO[(tb + r) * BW + h * 128 + 16 * sl + c] = num[r]; } \
          else if (c == 0) { _Pragma("unroll") for (int r = 0; r < 4; ++r) HDEN[(tb + r) * 4 + h] = num[r]; } } \
        LDS_BAR(); } while (0)
    for (int n = 0; n < T / 64; n += 2) {
        ml_load(F1, p, (n + 1) * 4 + h, offA, offV);
        ML_STEP(F0, n);
        ml_load(F0, p, ((n + 2 < T / 64) ? n + 2 : n) * 4 + h, offA, offV);
        ML_STEP(F1, n + 1);
    }
#undef ML_STEP
}


constexpr int QP = 132;
__device__ __forceinline__ void gdn_pre_item(const Params& p, int l, LAS unsigned char* lds, int item, int tid, int wave, int lane) {
    const int h = item & 3, n = item >> 2; const size_t t0 = (size_t)n * 64;
    const bf16* Z = (const bf16*)(p.ws + WS_Z); const float* SMALL = (const float*)(p.ws + WS_SMALL);
    float* GU = (float*)(p.ws + WS_GU) + (size_t)item * 8192; bf16* GNW = (bf16*)(p.ws + WS_GNW) + (size_t)item * 8192; bf16* GQG = (bf16*)(p.ws + WS_GQG) + (size_t)item * 8192;
    bf16* GAT = (bf16*)(p.ws + WS_GAT) + (size_t)item * 4096; bf16* GKT = (bf16*)(p.ws + WS_GKT) + (size_t)item * 8192; float* GDL = (float*)(p.ws + WS_GDL);
    const float* cw = p.in[I_CONVW] + (size_t)l * 4 * 1536;
    LAS float* qs = (LAS float*)lds; LAS float* ks = qs + 64 * QP; LAS float* vs = ks + 64 * QP; LAS float* Ls = vs + 64 * QP;   LAS float* gcs = Ls + 64 * 68; LAS float* bts = gcs + 64; LAS float* btg = bts + 64;
    { const int tk = tid >> 3, part = tid & 7;
#pragma unroll 1
      for (int i = 0; i < 3; ++i) { float a[16];
#pragma unroll
        for (int x = 0; x < 16; ++x) a[x] = 0.f;
#pragma unroll
        for (int j = 0; j < 4; ++j) { const long tt = (long)t0 + tk - 3 + j; if (tt >= 0) {
            const bf16* src = Z + (size_t)tt * ZC + ZC_GDN + i * 512 + h * 128 + 16 * part; float x0[8], x1[8]; unpack8(*(const v4u*)src, x0); unpack8(*(const v4u*)(src + 8), x1);
            const float* wp = cw + j * 1536 + i * 512 + h * 128 + 16 * part;
#pragma unroll
            for (int x = 0; x < 8; ++x) { a[x] += wp[x] * x0[x]; a[8 + x] += wp[8 + x] * x1[x]; } } }
        float ss = 0.f;
#pragma unroll
        for (int x = 0; x < 16; ++x) { a[x] = siluf_(a[x]); ss += a[x] * a[x]; }
        if (i < 2) { ss = sum8(ss); const float r = rsqrtf(ss + 1e-6f) * (i == 0 ? 0.08838834764831845f : 1.f);
#pragma unroll
            for (int x = 0; x < 16; ++x) a[x] *= r; }
        LAS float* dst = (i == 0 ? qs : (i == 1 ? ks : vs)) + tk * QP + 16 * part;
#pragma unroll
        for (int x4 = 0; x4 < 4; ++x4) *(LAS v4f*)(dst + 4 * x4) = (v4f){a[4 * x4], a[4 * x4 + 1], a[4 * x4 + 2], a[4 * x4 + 3]}; } }
    if (wave == 0) { const float bb = SMALL[(t0 + lane) * 16 + h], aa = SMALL[(t0 + lane) * 16 + 4 + h];
        const float g = -__expf(p.in[I_ALOG][l * 4 + h]) * softplusf_(aa + p.in[I_DTB][l * 4 + h]);
        const float gc = wave_scan_incl(g), bt = sigmoidf_(bb); gcs[lane] = gc; bts[lane] = bt; btg[lane] = bt * __expf(gc); }
    __syncthreads();
    { const int i = tid >> 3, jb = tid & 7; const float gi = gcs[i], bi = bts[i]; float dk[8], dq[8];
#pragma unroll
      for (int x = 0; x < 8; ++x) { dk[x] = 0.f; dq[x] = 0.f; }
      if (8 * jb <= i) {
#pragma unroll 2
          for (int d4 = 0; d4 < 32; ++d4) { const v4f qi = *(const LAS v4f*)(qs + i * QP + 4 * d4), ki = *(const LAS v4f*)(ks + i * QP + 4 * d4);
#pragma unroll
              for (int x = 0; x < 8; ++x) { const v4f kj = *(const LAS v4f*)(ks + (8 * jb + x) * QP + 4 * d4);
                  dk[x] += ki.x * kj.x + ki.y * kj.y + ki.z * kj.z + ki.w * kj.w; dq[x] += qi.x * kj.x + qi.y * kj.y + qi.z * kj.z + qi.w * kj.w; } }
#pragma unroll
          for (int x = 0; x < 8; ++x) { const int j = 8 * jb + x; const float dc = __expf(gi - gcs[j]); dk[x] = (j < i) ? bi * dk[x] * dc : 0.f; dq[x] = (j <= i) ? dq[x] * dc : 0.f; } }
      *(LAS v4f*)(Ls + i * 68 + 8 * jb) = (v4f){dk[0], dk[1], dk[2], dk[3]}; *(LAS v4f*)(Ls + i * 68 + 8 * jb + 4) = (v4f){dk[4], dk[5], dk[6], dk[7]};
      v4u w; w.x = pk2(dq[0], dq[1]); w.y = pk2(dq[2], dq[3]); w.z = pk2(dq[4], dq[5]); w.w = pk2(dq[6], dq[7]); *(v4u*)(GAT + i * 64 + 8 * jb) = w; }
    __syncthreads();
    if (tid < 256) {
        const int c = tid; int vz; asm volatile("v_mov_b32 %0, 0" : "=v"(vz));
        const LAS float* rp = (c < 128) ? (vs + c) : (ks + (c - 128)); const LAS float* mp = ((c < 128) ? bts : btg) + vz;
#define GDN_RHS(i) (rp[(i) * QP] * mp[(i)])
#define GDN_L4(i, j4) (*(const LAS v4f*)(Ls + (i) * 68 + 4 * (j4) + vz))
        float x0 = GDN_RHS(0); __builtin_amdgcn_sched_barrier(0);
        float x1 = GDN_RHS(1); { const v4f l = GDN_L4(1, 0); x1 -= l.x * x0; } __builtin_amdgcn_sched_barrier(0);
        float x2 = GDN_RHS(2); { const v4f l = GDN_L4(2, 0); x2 -= l.x * x0; x2 -= l.y * x1; } __builtin_amdgcn_sched_barrier(0);
        float x3 = GDN_RHS(3); { const v4f l = GDN_L4(3, 0); x3 -= l.x * x0; x3 -= l.y * x1; x3 -= l.z * x2; } __builtin_amdgcn_sched_barrier(0);
        float x4 = GDN_RHS(4); { const v4f l = GDN_L4(4, 0); x4 -= l.x * x0; x4 -= l.y * x1; x4 -= l.z * x2; x4 -= l.w * x3; } __builtin_amdgcn_sched_barrier(0);
        float x5 = GDN_RHS(5); { const v4f l = GDN_L4(5, 0); x5 -= l.x * x0; x5 -= l.y * x1; x5 -= l.z * x2; x5 -= l.w * x3; } { const v4f l = GDN_L4(5, 1); x5 -= l.x * x4; } __builtin_amdgcn_sched_barrier(0);
        float x6 = GDN_RHS(6); { const v4f l = GDN_L4(6, 0); x6 -= l.x * x0; x6 -= l.y * x1; x6 -= l.z * x2; x6 -= l.w * x3; } { const v4f l = GDN_L4(6, 1); x6 -= l.x * x4; x6 -= l.y * x5; } __builtin_amdgcn_sched_barrier(0);
        float x7 = GDN_RHS(7); { const v4f l = GDN_L4(7, 0); x7 -= l.x * x0; x7 -= l.y * x1; x7 -= l.z * x2; x7 -= l.w * x3; } { const v4f l = GDN_L4(7, 1); x7 -= l.x * x4; x7 -= l.y * x5; x7 -= l.z * x6; } __builtin_amdgcn_sched_barrier(0);
        float x8 = GDN_RHS(8); { const v4f l = GDN_L4(8, 0); x8 -= l.x * x0; x8 -= l.y * x1; x8 -= l.z * x2; x8 -= l.w * x3; } { const v4f l = GDN_L4(8, 1); x8 -= l.x * x4; x8 -= l.y * x5; x8 -= l.z * x6; x8 -= l.w * x7; } __builtin_amdgcn_sched_barrier(0);
        float x9 = GDN_RHS(9); { const v4f l = GDN_L4(9, 0); x9 -= l.x * x0; x9 -= l.y * x1; x9 -= l.z * x2; x9 -= l.w * x3; } { const v4f l = GDN_L4(9, 1); x9 -= l.x * x4; x9 -= l.y * x5; x9 -= l.z * x6; x9 -= l.w * x7; } { const v4f l = GDN_L4(9, 2); x9 -= l.x * x8; } __builtin_amdgcn_sched_barrier(0);
        float x10 = GDN_RHS(10); { const v4f l = GDN_L4(10, 0); x10 -= l.x * x0; x10 -= l.y * x1; x10 -= l.z * x2; x10 -= l.w * x3; } { const v4f l = GDN_L4(10, 1); x10 -= l.x * x4; x10 -= l.y * x5; x10 -= l.z * x6; x10 -= l.w * x7; } { const v4f l = GDN_L4(10, 2); x10 -= l.x * x8; x10 -= l.y * x9; } __builtin_amdgcn_sched_barrier(0);
        float x11 = GDN_RHS(11); { const v4f l = GDN_L4(11, 0); x11 -= l.x * x0; x11 -= l.y * x1; x11 -= l.z * x2; x11 -= l.w * x3; } { const v4f l = GDN_L4(11, 1); x11 -= l.x * x4; x11 -= l.y * x5; x11 -= l.z * x6; x11 -= l.w * x7; } { const v4f l = GDN_L4(11, 2); x11 -= l.x * x8; x11 -= l.y * x9; x11 -= l.z * x10; } __builtin_amdgcn_sched_barrier(0);
        float x12 = GDN_RHS(12); { const v4f l = GDN_L4(12, 0); x12 -= l.x * x0; x12 -= l.y * x1; x12 -= l.z * x2; x12 -= l.w * x3; } { const v4f l = GDN_L4(12, 1); x12 -= l.x * x4; x12 -= l.y * x5; x12 -= l.z * x6; x12 -= l.w * x7; } { const v4f l = GDN_L4(12, 2); x12 -= l.x * x8; x12 -= l.y * x9; x12 -= l.z * x10; x12 -= l.w * x11; } __builtin_amdgcn_sched_barrier(0);
        float x13 = GDN_RHS(13); { const v4f l = GDN_L4(13, 0); x13 -= l.x * x0; x13 -= l.y * x1; x13 -= l.z * x2; x13 -= l.w * x3; } { const v4f l = GDN_L4(13, 1); x13 -= l.x * x4; x13 -= l.y * x5; x13 -= l.z * x6; x13 -= l.w * x7; } { const v4f l = GDN_L4(13, 2); x13 -= l.x * x8; x13 -= l.y * x9; x13 -= l.z * x10; x13 -= l.w * x11; } { const v4f l = GDN_L4(13, 3); x13 -= l.x * x12; } __builtin_amdgcn_sched_barrier(0);
        float x14 = GDN_RHS(14); { const v4f l = GDN_L4(14, 0); x14 -= l.x * x0; x14 -= l.y * x1; x14 -= l.z * x2; x14 -= l.w * x3; } { const v4f l = GDN_L4(14, 1); x14 -= l.x * x4; x14 -= l.y * x5; x14 -= l.z * x6; x14 -= l.w * x7; } { const v4f l = GDN_L4(14, 2); x14 -= l.x * x8; x14 -= l.y * x9; x14 -= l.z * x10; x14 -= l.w * x11; } { const v4f l = GDN_L4(14, 3); x14 -= l.x * x12; x14 -= l.y * x13; } __builtin_amdgcn_sched_barrier(0);
        float x15 = GDN_RHS(15); { const v4f l = GDN_L4(15, 0); x15 -= l.x * x0; x15 -= l.y * x1; x15 -= l.z * x2; x15 -= l.w * x3; } { const v4f l = GDN_L4(15, 1); x15 -= l.x * x4; x15 -= l.y * x5; x15 -= l.z * x6; x15 -= l.w * x7; } { const v4f l = GDN_L4(15, 2); x15 -= l.x * x8; x15 -= l.y * x9; x15 -= l.z * x10; x15 -= l.w * x11; } { const v4f l = GDN_L4(15, 3); x15 -= l.x * x12; x15 -= l.y * x13; x15 -= l.z * x14; } __builtin_amdgcn_sched_barrier(0);
        float x16 = GDN_RHS(16); { const v4f l = GDN_L4(16, 0); x16 -= l.x * x0; x16 -= l.y * x1; x16 -= l.z * x2; x16 -= l.w * x3; } { const v4f l = GDN_L4(16, 1); x16 -= l.x * x4; x16 -= l.y * x5; x16 -= l.z * x6; x16 -= l.w * x7; } { const v4f l = GDN_L4(16, 2); x16 -= l.x * x8; x16 -= l.y * x9; x16 -= l.z * x10; x16 -= l.w * x11; } { const v4f l = GDN_L4(16, 3); x16 -= l.x * x12; x16 -= l.y * x13; x16 -= l.z * x14; x16 -= l.w * x15; } __builtin_amdgcn_sched_barrier(0);
        float x17 = GDN_RHS(17); { const v4f l = GDN_L4(17, 0); x17 -= l.x * x0; x17 -= l.y * x1; x17 -= l.z * x2; x17 -= l.w * x3; } { const v4f l = GDN_L4(17, 1); x17 -= l.x * x4; x17 -= l.y * x5; x17 -= l.z * x6; x17 -= l.w * x7; } { const v4f l = GDN_L4(17, 2); x17 -= l.x * x8; x17 -= l.y * x9; x17 -= l.z * x10; x17 -= l.w * x11; } { const v4f l = GDN_L4(17, 3); x17 -= l.x * x12; x17 -= l.y * x13; x17 -= l.z * x14; x17 -= l.w * x15; } { const v4f l = GDN_L4(17, 4); x17 -= l.x * x16; } __builtin_amdgcn_sched_barrier(0);
        float x18 = GDN_RHS(18); { const v4f l = GDN_L4(18, 0); x18 -= l.x * x0; x18 -= l.y * x1; x18 -= l.z * x2; x18 -= l.w * x3; } { const v4f l = GDN_L4(18, 1); x18 -= l.x * x4; x18 -= l.y * x5; x18 -= l.z * x6; x18 -= l.w * x7; } { const v4f l = GDN_L4(18, 2); x18 -= l.x * x8; x18 -= l.y * x9; x18 -= l.z * x10; x18 -= l.w * x11; } { const v4f l = GDN_L4(18, 3); x18 -= l.x * x12; x18 -= l.y * x13; x18 -= l.z * x14; x18 -= l.w * x15; } { const v4f l = GDN_L4(18, 4); x18 -= l.x * x16; x18 -= l.y * x17; } __builtin_amdgcn_sched_barrier(0);
        float x19 = GDN_RHS(19); { const v4f l = GDN_L4(19, 0); x19 -= l.x * x0; x19 -= l.y * x1; x19 -= l.z * x2; x19 -= l.w * x3; } { const v4f l = GDN_L4(19, 1); x19 -= l.x * x4; x19 -= l.y * x5; x19 -= l.z * x6; x19 -= l.w * x7; } { const v4f l = GDN_L4(19, 2); x19 -= l.x * x8; x19 -= l.y * x9; x19 -= l.z * x10; x19 -= l.w * x11; } { const v4f l = GDN_L4(19, 3); x19 -= l.x * x12; x19 -= l.y * x13; x19 -= l.z * x14; x19 -= l.w * x15; } { const v4f l = GDN_L4(19, 4); x19 -= l.x * x16; x19 -= l.y * x17; x19 -= l.z * x18; } __builtin_amdgcn_sched_barrier(0);
        float x20 = GDN_RHS(20); { const v4f l = GDN_L4(20, 0); x20 -= l.x * x0; x20 -= l.y * x1; x20 -= l.z * x2; x20 -= l.w * x3; } { const v4f l = GDN_L4(20, 1); x20 -= l.x * x4; x20 -= l.y * x5; x20 -= l.z * x6; x20 -= l.w * x7; } { const v4f l = GDN_L4(20, 2); x20 -= l.x * x8; x20 -= l.y * x9; x20 -= l.z * x10; x20 -= l.w * x11; } { const v4f l = GDN_L4(20, 3); x20 -= l.x * x12; x20 -= l.y * x13; x20 -= l.z * x14; x20 -= l.w * x15; } { const v4f l = GDN_L4(20, 4); x20 -= l.x * x16; x20 -= l.y * x17; x20 -= l.z * x18; x20 -= l.w * x19; } __builtin_amdgcn_sched_barrier(0);
        float x21 = GDN_RHS(21); { const v4f l = GDN_L4(21, 0); x21 -= l.x * x0; x21 -= l.y * x1; x21 -= l.z * x2; x21 -= l.w * x3; } { const v4f l = GDN_L4(21, 1); x21 -= l.x * x4; x21 -= l.y * x5; x21 -= l.z * x6; x21 -= l.w * x7; } { const v4f l = GDN_L4(21, 2); x21 -= l.x * x8; x21 -= l.y * x9; x21 -= l.z * x10; x21 -= l.w * x11; } { const v4f l = GDN_L4(21, 3); x21 -= l.x * x12; x21 -= l.y * x13; x21 -= l.z * x14; x21 -= l.w * x15; } { const v4f l = GDN_L4(21, 4); x21 -= l.x * x16; x21 -= l.y * x17; x21 -= l.z * x18; x21 -= l.w * x19; } { const v4f l = GDN_L4(21, 5); x21 -= l.x * x20; } __builtin_amdgcn_sched_barrier(0);
        float x22 = GDN_RHS(22); { const v4f l = GDN_L4(22, 0); x22 -= l.x * x0; x22 -= l.y * x1; x22 -= l.z * x2; x22 -= l.w * x3; } { const v4f l = GDN_L4(22, 1); x22 -= l.x * x4; x22 -= l.y * x5; x22 -= l.z * x6; x22 -= l.w * x7; } { const v4f l = GDN_L4(22, 2); x22 -= l.x * x8; x22 -= l.y * x9; x22 -= l.z * x10; x22 -= l.w * x11; } { const v4f l = GDN_L4(22, 3); x22 -= l.x * x12; x22 -= l.y * x13; x22 -= l.z * x14; x22 -= l.w * x15; } { const v4f l = GDN_L4(22, 4); x22 -= l.x * x16; x22 -= l.y * x17; x22 -= l.z * x18; x22 -= l.w * x19; } { const v4f l = GDN_L4(22, 5); x22 -= l.x * x20; x22 -= l.y * x21; } __builtin_amdgcn_sched_barrier(0);
        float x23 = GDN_RHS(23); { const v4f l = GDN_L4(23, 0); x23 -= l.x * x0; x23 -= l.y * x1; x23 -= l.z * x2; x23 -= l.w * x3; } { const v4f l = GDN_L4(23, 1); x23 -= l.x * x4; x23 -= l.y * x5; x23 -= l.z * x6; x23 -= l.w * x7; } { const v4f l = GDN_L4(23, 2); x23 -= l.x * x8; x23 -= l.y * x9; x23 -= l.z * x10; x23 -= l.w * x11; } { const v4f l = GDN_L4(23, 3); x23 -= l.x * x12; x23 -= l.y * x13; x23 -= l.z * x14; x23 -= l.w * x15; } { const v4f l = GDN_L4(23, 4); x23 -= l.x * x16; x23 -= l.y * x17; x23 -= l.z * x18; x23 -= l.w * x19; } { const v4f l = GDN_L4(23, 5); x23 -= l.x * x20; x23 -= l.y * x21; x23 -= l.z * x22; } __builtin_amdgcn_sched_barrier(0);
        float x24 = GDN_RHS(24); { const v4f l = GDN_L4(24, 0); x24 -= l.x * x0; x24 -= l.y * x1; x24 -= l.z * x2; x24 -= l.w * x3; } { const v4f l = GDN_L4(24, 1); x24 -= l.x * x4; x24 -= l.y * x5; x24 -= l.z * x6; x24 -= l.w * x7; } { const v4f l = GDN_L4(24, 2); x24 -= l.x * x8; x24 -= l.y * x9; x24 -= l.z * x10; x24 -= l.w * x11; } { const v4f l = GDN_L4(24, 3); x24 -= l.x * x12; x24 -= l.y * x13; x24 -= l.z * x14; x24 -= l.w * x15; } { const v4f l = GDN_L4(24, 4); x24 -= l.x * x16; x24 -= l.y * x17; x24 -= l.z * x18; x24 -= l.w * x19; } { const v4f l = GDN_L4(24, 5); x24 -= l.x * x20; x24 -= l.y * x21; x24 -= l.z * x22; x24 -= l.w * x23; } __builtin_amdgcn_sched_barrier(0);
        float x25 = GDN_RHS(25); { const v4f l = GDN_L4(25, 0); x25 -= l.x * x0; x25 -= l.y * x1; x25 -= l.z * x2; x25 -= l.w * x3; } { const v4f l = GDN_L4(25, 1); x25 -= l.x * x4; x25 -= l.y * x5; x25 -= l.z * x6; x25 -= l.w * x7; } { const v4f l = GDN_L4(25, 2); x25 -= l.x * x8; x25 -= l.y * x9; x25 -= l.z * x10; x25 -= l.w * x11; } { const v4f l = GDN_L4(25, 3); x25 -= l.x * x12; x25 -= l.y * x13; x25 -= l.z * x14; x25 -= l.w * x15; } { const v4f l = GDN_L4(25, 4); x25 -= l.x * x16; x25 -= l.y * x17; x25 -= l.z * x18; x25 -= l.w * x19; } { const v4f l = GDN_L4(25, 5); x25 -= l.x * x20; x25 -= l.y * x21; x25 -= l.z * x22; x25 -= l.w * x23; } { const v4f l = GDN_L4(25, 6); x25 -= l.x * x24; } __builtin_amdgcn_sched_barrier(0);
        float x26 = GDN_RHS(26); { const v4f l = GDN_L4(26, 0); x26 -= l.x * x0; x26 -= l.y * x1; x26 -= l.z * x2; x26 -= l.w * x3; } { const v4f l = GDN_L4(26, 1); x26 -= l.x * x4; x26 -= l.y * x5; x26 -= l.z * x6; x26 -= l.w * x7; } { const v4f l = GDN_L4(26, 2); x26 -= l.x * x8; x26 -= l.y * x9; x26 -= l.z * x10; x26 -= l.w * x11; } { const v4f l = GDN_L4(26, 3); x26 -= l.x * x12; x26 -= l.y * x13; x26 -= l.z * x14; x26 -= l.w * x15; } { const v4f l = GDN_L4(26, 4); x26 -= l.x * x16; x26 -= l.y * x17; x26 -= l.z * x18; x26 -= l.w * x19; } { const v4f l = GDN_L4(26, 5); x26 -= l.x * x20; x26 -= l.y * x21; x26 -= l.z * x22; x26 -= l.w * x23; } { const v4f l = GDN_L4(26, 6); x26 -= l.x * x24; x26 -= l.y * x25; } __builtin_amdgcn_sched_barrier(0);
        float x27 = GDN_RHS(27); { const v4f l = GDN_L4(27, 0); x27 -= l.x * x0; x27 -= l.y * x1; x27 -= l.z * x2; x27 -= l.w * x3; } { const v4f l = GDN_L4(27, 1); x27 -= l.x * x4; x27 -= l.y * x5; x27 -= l.z * x6; x27 -= l.w * x7; } { const v4f l = GDN_L4(27, 2); x27 -= l.x * x8; x27 -= l.y * x9; x27 -= l.z * x10; x27 -= l.w * x11; } { const v4f l = GDN_L4(27, 3); x27 -= l.x * x12; x27 -= l.y * x13; x27 -= l.z * x14; x27 -= l.w * x15; } { const v4f l = GDN_L4(27, 4); x27 -= l.x * x16; x27 -= l.y * x17; x27 -= l.z * x18; x27 -= l.w * x19; } { const v4f l = GDN_L4(27, 5); x27 -= l.x * x20; x27 -= l.y * x21; x27 -= l.z * x22; x27 -= l.w * x23; } { const v4f l = GDN_L4(27, 6); x27 -= l.x * x24; x27 -= l.y * x25; x27 -= l.z * x26; } __builtin_amdgcn_sched_barrier(0);
        float x28 = GDN_RHS(28); { const v4f l = GDN_L4(28, 0); x28 -= l.x * x0; x28 -= l.y * x1; x28 -= l.z * x2; x28 -= l.w * x3; } { const v4f l = GDN_L4(28, 1); x28 -= l.x * x4; x28 -= l.y * x5; x28 -= l.z * x6; x28 -= l.w * x7; } { const v4f l = GDN_L4(28, 2); x28 -= l.x * x8; x28 -= l.y * x9; x28 -= l.z * x10; x28 -= l.w * x11; } { const v4f l = GDN_L4(28, 3); x28 -= l.x * x12; x28 -= l.y * x13; x28 -= l.z * x14; x28 -= l.w * x15; } { const v4f l = GDN_L4(28, 4); x28 -= l.x * x16; x28 -= l.y * x17; x28 -= l.z * x18; x28 -= l.w * x19; } { const v4f l = GDN_L4(28, 5); x28 -= l.x * x20; x28 -= l.y * x21; x28 -= l.z * x22; x28 -= l.w * x23; } { const v4f l = GDN_L4(28, 6); x28 -= l.x * x24; x28 -= l.y * x25; x28 -= l.z * x26; x28 -= l.w * x27; } __builtin_amdgcn_sched_barrier(0);
        float x29 = GDN_RHS(29); { const v4f l = GDN_L4(29, 0); x29 -= l.x * x0; x29 -= l.y * x1; x29 -= l.z * x2; x29 -= l.w * x3; } { const v4f l = GDN_L4(29, 1); x29 -= l.x * x4; x29 -= l.y * x5; x29 -= l.z * x6; x29 -= l.w * x7; } { const v4f l = GDN_L4(29, 2); x29 -= l.x * x8; x29 -= l.y * x9; x29 -= l.z * x10; x29 -= l.w * x11; } { const v4f l = GDN_L4(29, 3); x29 -= l.x * x12; x29 -= l.y * x13; x29 -= l.z * x14; x29 -= l.w * x15; } { const v4f l = GDN_L4(29, 4); x29 -= l.x * x16; x29 -= l.y * x17; x29 -= l.z * x18; x29 -= l.w * x19; } { const v4f l = GDN_L4(29, 5); x29 -= l.x * x20; x29 -= l.y * x21; x29 -= l.z * x22; x29 -= l.w * x23; } { const v4f l = GDN_L4(29, 6); x29 -= l.x * x24; x29 -= l.y * x25; x29 -= l.z * x26; x29 -= l.w * x27; } { const v4f l = GDN_L4(29, 7); x29 -= l.x * x28; } __builtin_amdgcn_sched_barrier(0);
        float x30 = GDN_RHS(30); { const v4f l = GDN_L4(30, 0); x30 -= l.x * x0; x30 -= l.y * x1; x30 -= l.z * x2; x30 -= l.w * x3; } { const v4f l = GDN_L4(30, 1); x30 -= l.x * x4; x30 -= l.y * x5; x30 -= l.z * x6; x30 -= l.w * x7; } { const v4f l = GDN_L4(30, 2); x30 -= l.x * x8; x30 -= l.y * x9; x30 -= l.z * x10; x30 -= l.w * x11; } { const v4f l = GDN_L4(30, 3); x30 -= l.x * x12; x30 -= l.y * x13; x30 -= l.z * x14; x30 -= l.w * x15; } { const v4f l = GDN_L4(30, 4); x30 -= l.x * x16; x30 -= l.y * x17; x30 -= l.z * x18; x30 -= l.w * x19; } { const v4f l = GDN_L4(30, 5); x30 -= l.x * x20; x30 -= l.y * x21; x30 -= l.z * x22; x30 -= l.w * x23; } { const v4f l = GDN_L4(30, 6); x30 -= l.x * x24; x30 -= l.y * x25; x30 -= l.z * x26; x30 -= l.w * x27; } { const v4f l = GDN_L4(30, 7); x30 -= l.x * x28; x30 -= l.y * x29; } __builtin_amdgcn_sched_barrier(0);
        float x31 = GDN_RHS(31); { const v4f l = GDN_L4(31, 0); x31 -= l.x * x0; x31 -= l.y * x1; x31 -= l.z * x2; x31 -= l.w * x3; } { const v4f l = GDN_L4(31, 1); x31 -= l.x * x4; x31 -= l.y * x5; x31 -= l.z * x6; x31 -= l.w * x7; } { const v4f l = GDN_L4(31, 2); x31 -= l.x * x8; x31 -= l.y * x9; x31 -= l.z * x10; x31 -= l.w * x11; } { const v4f l = GDN_L4(31, 3); x31 -= l.x * x12; x31 -= l.y * x13; x31 -= l.z * x14; x31 -= l.w * x15; } { const v4f l = GDN_L4(31, 4); x31 -= l.x * x16; x31 -= l.y * x17; x31 -= l.z * x18; x31 -= l.w * x19; } { const v4f l = GDN_L4(31, 5); x31 -= l.x * x20; x31 -= l.y * x21; x31 -= l.z * x22; x31 -= l.w * x23; } { const v4f l = GDN_L4(31, 6); x31 -= l.x * x24; x31 -= l.y * x25; x31 -= l.z * x26; x31 -= l.w * x27; } { const v4f l = GDN_L4(31, 7); x31 -= l.x * x28; x31 -= l.y * x29; x31 -= l.z * x30; } __builtin_amdgcn_sched_barrier(0);
        float x32 = GDN_RHS(32); { const v4f l = GDN_L4(32, 0); x32 -= l.x * x0; x32 -= l.y * x1; x32 -= l.z * x2; x32 -= l.w * x3; } { const v4f l = GDN_L4(32, 1); x32 -= l.x * x4; x32 -= l.y * x5; x32 -= l.z * x6; x32 -= l.w * x7; } { const v4f l = GDN_L4(32, 2); x32 -= l.x * x8; x32 -= l.y * x9; x32 -= l.z * x10; x32 -= l.w * x11; } { const v4f l = GDN_L4(32, 3); x32 -= l.x * x12; x32 -= l.y * x13; x32 -= l.z * x14; x32 -= l.w * x15; } { const v4f l = GDN_L4(32, 4); x32 -= l.x * x16; x32 -= l.y * x17; x32 -= l.z * x18; x32 -= l.w * x19; } { const v4f l = GDN_L4(32, 5); x32 -= l.x * x20; x32 -= l.y * x21; x32 -= l.z * x22; x32 -= l.w * x23; } { const v4f l = GDN_L4(32, 6); x32 -= l.x * x24; x32 -= l.y * x25; x32 -= l.z * x26; x32 -= l.w * x27; } { const v4f l = GDN_L4(32, 7); x32 -= l.x * x28; x32 -= l.y * x29; x32 -= l.z * x30; x32 -= l.w * x31; } __builtin_amdgcn_sched_barrier(0);
        float x33 = GDN_RHS(33); { const v4f l = GDN_L4(33, 0); x33 -= l.x * x0; x33 -= l.y * x1; x33 -= l.z * x2; x33 -= l.w * x3; } { const v4f l = GDN_L4(33, 1); x33 -= l.x * x4; x33 -= l.y * x5; x33 -= l.z * x6; x33 -= l.w * x7; } { const v4f l = GDN_L4(33, 2); x33 -= l.x * x8; x33 -= l.y * x9; x33 -= l.z * x10; x33 -= l.w * x11; } { const v4f l = GDN_L4(33, 3); x33 -= l.x * x12; x33 -= l.y * x13; x33 -= l.z * x14; x33 -= l.w * x15; } { const v4f l = GDN_L4(33, 4); x33 -= l.x * x16; x33 -= l.y * x17; x33 -= l.z * x18; x33 -= l.w * x19; } { const v4f l = GDN_L4(33, 5); x33 -= l.x * x20; x33 -= l.y * x21; x33 -= l.z * x22; x33 -= l.w * x23; } { const v4f l = GDN_L4(33, 6); x33 -= l.x * x24; x33 -= l.y * x25; x33 -= l.z * x26; x33 -= l.w * x27; } { const v4f l = GDN_L4(33, 7); x33 -= l.x * x28; x33 -= l.y * x29; x33 -= l.z * x30; x33 -= l.w * x31; } { const v4f l = GDN_L4(33, 8); x33 -= l.x * x32; } __builtin_amdgcn_sched_barrier(0);
        float x34 = GDN_RHS(34); { const v4f l = GDN_L4(34, 0); x34 -= l.x * x0; x34 -= l.y * x1; x34 -= l.z * x2; x34 -= l.w * x3; } { const v4f l = GDN_L4(34, 1); x34 -= l.x * x4; x34 -= l.y * x5; x34 -= l.z * x6; x34 -= l.w * x7; } { const v4f l = GDN_L4(34, 2); x34 -= l.x * x8; x34 -= l.y * x9; x34 -= l.z * x10; x34 -= l.w * x11; } { const v4f l = GDN_L4(34, 3); x34 -= l.x * x12; x34 -= l.y * x13; x34 -= l.z * x14; x34 -= l.w * x15; } { const v4f l = GDN_L4(34, 4); x34 -= l.x * x16; x34 -= l.y * x17; x34 -= l.z * x18; x34 -= l.w * x19; } { const v4f l = GDN_L4(34, 5); x34 -= l.x * x20; x34 -= l.y * x21; x34 -= l.z * x22; x34 -= l.w * x23; } { const v4f l = GDN_L4(34, 6); x34 -= l.x * x24; x34 -= l.y * x25; x34 -= l.z * x26; x34 -= l.w * x27; } { const v4f l = GDN_L4(34, 7); x34 -= l.x * x28; x34 -= l.y * x29; x34 -= l.z * x30; x34 -= l.w * x31; } { const v4f l = GDN_L4(34, 8); x34 -= l.x * x32; x34 -= l.y * x33; } __builtin_amdgcn_sched_barrier(0);
        float x35 = GDN_RHS(35); { const v4f l = GDN_L4(35, 0); x35 -= l.x * x0; x35 -= l.y * x1; x35 -= l.z * x2; x35 -= l.w * x3; } { const v4f l = GDN_L4(35, 1); x35 -= l.x * x4; x35 -= l.y * x5; x35 -= l.z * x6; x35 -= l.w * x7; } { const v4f l = GDN_L4(35, 2); x35 -= l.x * x8; x35 -= l.y * x9; x35 -= l.z * x10; x35 -= l.w * x11; } { const v4f l = GDN_L4(35, 3); x35 -= l.x * x12; x35 -= l.y * x13; x35 -= l.z * x14; x35 -= l.w * x15; } { const v4f l = GDN_L4(35, 4); x35 -= l.x * x16; x35 -= l.y * x17; x35 -= l.z * x18; x35 -= l.w * x19; } { const v4f l = GDN_L4(35, 5); x35 -= l.x * x20; x35 -= l.y * x21; x35 -= l.z * x22; x35 -= l.w * x23; } { const v4f l = GDN_L4(35, 6); x35 -= l.x * x24; x35 -= l.y * x25; x35 -= l.z * x26; x35 -= l.w * x27; } { const v4f l = GDN_L4(35, 7); x35 -= l.x * x28; x35 -= l.y * x29; x35 -= l.z * x30; x35 -= l.w * x31; } { const v4f l = GDN_L4(35, 8); x35 -= l.x * x32; x35 -= l.y * x33; x35 -= l.z * x34; } __builtin_amdgcn_sched_barrier(0);
        float x36 = GDN_RHS(36); { const v4f l = GDN_L4(36, 0); x36 -= l.x * x0; x36 -= l.y * x1; x36 -= l.z * x2; x36 -= l.w * x3; } { const v4f l = GDN_L4(36, 1); x36 -= l.x * x4; x36 -= l.y * x5; x36 -= l.z * x6; x36 -= l.w * x7; } { const v4f l = GDN_L4(36, 2); x36 -= l.x * x8; x36 -= l.y * x9; x36 -= l.z * x10; x36 -= l.w * x11; } { const v4f l = GDN_L4(36, 3); x36 -= l.x * x12; x36 -= l.y * x13; x36 -= l.z * x14; x36 -= l.w * x15; } { const v4f l = GDN_L4(36, 4); x36 -= l.x * x16; x36 -= l.y * x17; x36 -= l.z * x18; x36 -= l.w * x19; } { const v4f l = GDN_L4(36, 5); x36 -= l.x * x20; x36 -= l.y * x21; x36 -= l.z * x22; x36 -= l.w * x23; } { const v4f l = GDN_L4(36, 6); x36 -= l.x * x24; x36 -= l.y * x25; x36 -= l.z * x26; x36 -= l.w * x27; } { const v4f l = GDN_L4(36, 7); x36 -= l.x * x28; x36 -= l.y * x29; x36 -= l.z * x30; x36 -= l.w * x31; } { const v4f l = GDN_L4(36, 8); x36 -= l.x * x32; x36 -= l.y * x33; x36 -= l.z * x34; x36 -= l.w * x35; } __builtin_amdgcn_sched_barrier(0);
        float x37 = GDN_RHS(37); { const v4f l = GDN_L4(37, 0); x37 -= l.x * x0; x37 -= l.y * x1; x37 -= l.z * x2; x37 -= l.w * x3; } { const v4f l = GDN_L4(37, 1); x37 -= l.x * x4; x37 -= l.y * x5; x37 -= l.z * x6; x37 -= l.w * x7; } { const v4f l = GDN_L4(37, 2); x37 -= l.x * x8; x37 -= l.y * x9; x37 -= l.z * x10; x37 -= l.w * x11; } { const v4f l = GDN_L4(37, 3); x37 -= l.x * x12; x37 -= l.y * x13; x37 -= l.z * x14; x37 -= l.w * x15; } { const v4f l = GDN_L4(37, 4); x37 -= l.x * x16; x37 -= l.y * x17; x37 -= l.z * x18; x37 -= l.w * x19; } { const v4f l = GDN_L4(37, 5); x37 -= l.x * x20; x37 -= l.y * x21; x37 -= l.z * x22; x37 -= l.w * x23; } { const v4f l = GDN_L4(37, 6); x37 -= l.x * x24; x37 -= l.y * x25; x37 -= l.z * x26; x37 -= l.w * x27; } { const v4f l = GDN_L4(37, 7); x37 -= l.x * x28; x37 -= l.y * x29; x37 -= l.z * x30; x37 -= l.w * x31; } { const v4f l = GDN_L4(37, 8); x37 -= l.x * x32; x37 -= l.y * x33; x37 -= l.z * x34; x37 -= l.w * x35; } { const v4f l = GDN_L4(37, 9); x37 -= l.x * x36; } __builtin_amdgcn_sched_barrier(0);
        float x38 = GDN_RHS(38); { const v4f l = GDN_L4(38, 0); x38 -= l.x * x0; x38 -= l.y * x1; x38 -= l.z * x2; x38 -= l.w * x3; } { const v4f l = GDN_L4(38, 1); x38 -= l.x * x4; x38 -= l.y * x5; x38 -= l.z * x6; x38 -= l.w * x7; } { const v4f l = GDN_L4(38, 2); x38 -= l.x * x8; x38 -= l.y * x9; x38 -= l.z * x10; x38 -= l.w * x11; } { const v4f l = GDN_L4(38, 3); x38 -= l.x * x12; x38 -= l.y * x13; x38 -= l.z * x14; x38 -= l.w * x15; } { const v4f l = GDN_L4(38, 4); x38 -= l.x * x16; x38 -= l.y * x17; x38 -= l.z * x18; x38 -= l.w * x19; } { const v4f l = GDN_L4(38, 5); x38 -= l.x * x20; x38 -= l.y * x21; x38 -= l.z * x22; x38 -= l.w * x23; } { const v4f l = GDN_L4(38, 6); x38 -= l.x * x24; x38 -= l.y * x25; x38 -= l.z * x26; x38 -= l.w * x27; } { const v4f l = GDN_L4(38, 7); x38 -= l.x * x28; x38 -= l.y * x29; x38 -= l.z * x30; x38 -= l.w * x31; } { const v4f l = GDN_L4(38, 8); x38 -= l.x * x32; x38 -= l.y * x33; x38 -= l.z * x34; x38 -= l.w * x35; } { const v4f l = GDN_L4(38, 9); x38 -= l.x * x36; x38 -= l.y * x37; } __builtin_amdgcn_sched_barrier(0);
        float x39 = GDN_RHS(39); { const v4f l = GDN_L4(39, 0); x39 -= l.x * x0; x39 -= l.y * x1; x39 -= l.z * x2; x39 -= l.w * x3; } { const v4f l = GDN_L4(39, 1); x39 -= l.x * x4; x39 -= l.y * x5; x39 -= l.z * x6; x39 -= l.w * x7; } { const v4f l = GDN_L4(39, 2); x39 -= l.x * x8; x39 -= l.y * x9; x39 -= l.z * x10; x39 -= l.w * x11; } { const v4f l = GDN_L4(39, 3); x39 -= l.x * x12; x39 -= l.y * x13; x39 -= l.z * x14; x39 -= l.w * x15; } { const v4f l = GDN_L4(39, 4); x39 -= l.x * x16; x39 -= l.y * x17; x39 -= l.z * x18; x39 -= l.w * x19; } { const v4f l = GDN_L4(39, 5); x39 -= l.x * x20; x39 -= l.y * x21; x39 -= l.z * x22; x39 -= l.w * x23; } { const v4f l = GDN_L4(39, 6); x39 -= l.x * x24; x39 -= l.y * x25; x39 -= l.z * x26; x39 -= l.w * x27; } { const v4f l = GDN_L4(39, 7); x39 -= l.x * x28; x39 -= l.y * x29; x39 -= l.z * x30; x39 -= l.w * x31; } { const v4f l = GDN_L4(39, 8); x39 -= l.x * x32; x39 -= l.y * x33; x39 -= l.z * x34; x39 -= l.w * x35; } { const v4f l = GDN_L4(39, 9); x39 -= l.x * x36; x39 -= l.y * x37; x39 -= l.z * x38; } __builtin_amdgcn_sched_barrier(0);
        float x40 = GDN_RHS(40); { const v4f l = GDN_L4(40, 0); x40 -= l.x * x0; x40 -= l.y * x1; x40 -= l.z * x2; x40 -= l.w * x3; } { const v4f l = GDN_L4(40, 1); x40 -= l.x * x4; x40 -= l.y * x5; x40 -= l.z * x6; x40 -= l.w * x7; } { const v4f l = GDN_L4(40, 2); x40 -= l.x * x8; x40 -= l.y * x9; x40 -= l.z * x10; x40 -= l.w * x11; } { const v4f l = GDN_L4(40, 3); x40 -= l.x * x12; x40 -= l.y * x13; x40 -= l.z * x14; x40 -= l.w * x15; } { const v4f l = GDN_L4(40, 4); x40 -= l.x * x16; x40 -= l.y * x17; x40 -= l.z * x18; x40 -= l.w * x19; } { const v4f l = GDN_L4(40, 5); x40 -= l.x * x20; x40 -= l.y * x21; x40 -= l.z * x22; x40 -= l.w * x23; } { const v4f l = GDN_L4(40, 6); x40 -= l.x * x24; x40 -= l.y * x25; x40 -= l.z * x26; x40 -= l.w * x27; } { const v4f l = GDN_L4(40, 7); x40 -= l.x * x28; x40 -= l.y * x29; x40 -= l.z * x30; x40 -= l.w * x31; } { const v4f l = GDN_L4(40, 8); x40 -= l.x * x32; x40 -= l.y * x33; x40 -= l.z * x34; x40 -= l.w * x35; } { const v4f l = GDN_L4(40, 9); x40 -= l.x * x36; x40 -= l.y * x37; x40 -= l.z * x38; x40 -= l.w * x39; } __builtin_amdgcn_sched_barrier(0);
        float x41 = GDN_RHS(41); { const v4f l = GDN_L4(41, 0); x41 -= l.x * x0; x41 -= l.y * x1; x41 -= l.z * x2; x41 -= l.w * x3; } { const v4f l = GDN_L4(41, 1); x41 -= l.x * x4; x41 -= l.y * x5; x41 -= l.z * x6; x41 -= l.w * x7; } { const v4f l = GDN_L4(41, 2); x41 -= l.x * x8; x41 -= l.y * x9; x41 -= l.z * x10; x41 -= l.w * x11; } { const v4f l = GDN_L4(41, 3); x41 -= l.x * x12; x41 -= l.y * x13; x41 -= l.z * x14; x41 -= l.w * x15; } { const v4f l = GDN_L4(41, 4); x41 -= l.x * x16; x41 -= l.y * x17; x41 -= l.z * x18; x41 -= l.w * x19; } { const v4f l = GDN_L4(41, 5); x41 -= l.x * x20; x41 -= l.y * x21; x41 -= l.z * x22; x41 -= l.w * x23; } { const v4f l = GDN_L4(41, 6); x41 -= l.x * x24; x41 -= l.y * x25; x41 -= l.z * x26; x41 -= l.w * x27; } { const v4f l = GDN_L4(41, 7); x41 -= l.x * x28; x41 -= l.y * x29; x41 -= l.z * x30; x41 -= l.w * x31; } { const v4f l = GDN_L4(41, 8); x41 -= l.x * x32; x41 -= l.y * x33; x41 -= l.z * x34; x41 -= l.w * x35; } { const v4f l = GDN_L4(41, 9); x41 -= l.x * x36; x41 -= l.y * x37; x41 -= l.z * x38; x41 -= l.w * x39; } { const v4f l = GDN_L4(41, 10); x41 -= l.x * x40; } __builtin_amdgcn_sched_barrier(0);
        float x42 = GDN_RHS(42); { const v4f l = GDN_L4(42, 0); x42 -= l.x * x0; x42 -= l.y * x1; x42 -= l.z * x2; x42 -= l.w * x3; } { const v4f l = GDN_L4(42, 1); x42 -= l.x * x4; x42 -= l.y * x5; x42 -= l.z * x6; x42 -= l.w * x7; } { const v4f l = GDN_L4(42, 2); x42 -= l.x * x8; x42 -= l.y * x9; x42 -= l.z * x10; x42 -= l.w * x11; } { const v4f l = GDN_L4(42, 3); x42 -= l.x * x12; x42 -= l.y * x13; x42 -= l.z * x14; x42 -= l.w * x15; } { const v4f l = GDN_L4(42, 4); x42 -= l.x * x16; x42 -= l.y * x17; x42 -= l.z * x18; x42 -= l.w * x19; } { const v4f l = GDN_L4(42, 5); x42 -= l.x * x20; x42 -= l.y * x21; x42 -= l.z * x22; x42 -= l.w * x23; } { const v4f l = GDN_L4(42, 6); x42 -= l.x * x24; x42 -= l.y * x25; x42 -= l.z * x26; x42 -= l.w * x27; } { const v4f l = GDN_L4(42, 7); x42 -= l.x * x28; x42 -= l.y * x29; x42 -= l.z * x30; x42 -= l.w * x31; } { const v4f l = GDN_L4(42, 8); x42 -= l.x * x32; x42 -= l.y * x33; x42 -= l.z * x34; x42 -= l.w * x35; } { const v4f l = GDN_L4(42, 9); x42 -= l.x * x36; x42 -= l.y * x37; x42 -= l.z * x38; x42 -= l.w * x39; } { const v4f l = GDN_L4(42, 10); x42 -= l.x * x40; x42 -= l.y * x41; } __builtin_amdgcn_sched_barrier(0);
        float x43 = GDN_RHS(43); { const v4f l = GDN_L4(43, 0); x43 -= l.x * x0; x43 -= l.y * x1; x43 -= l.z * x2; x43 -= l.w * x3; } { const v4f l = GDN_L4(43, 1); x43 -= l.x * x4; x43 -= l.y * x5; x43 -= l.z * x6; x43 -= l.w * x7; } { const v4f l = GDN_L4(43, 2); x43 -= l.x * x8; x43 -= l.y * x9; x43 -= l.z * x10; x43 -= l.w * x11; } { const v4f l = GDN_L4(43, 3); x43 -= l.x * x12; x43 -= l.y * x13; x43 -= l.z * x14; x43 -= l.w * x15; } { const v4f l = GDN_L4(43, 4); x43 -= l.x * x16; x43 -= l.y * x17; x43 -= l.z * x18; x43 -= l.w * x19; } { const v4f l = GDN_L4(43, 5); x43 -= l.x * x20; x43 -= l.y * x21; x43 -= l.z * x22; x43 -= l.w * x23; } { const v4f l = GDN_L4(43, 6); x43 -= l.x * x24; x43 -= l.y * x25; x43 -= l.z * x26; x43 -= l.w * x27; } { const v4f l = GDN_L4(43, 7); x43 -= l.x * x28; x43 -= l.y * x29; x43 -= l.z * x30; x43 -= l.w * x31; } { const v4f l = GDN_L4(43, 8); x43 -= l.x * x32; x43 -= l.y * x33; x43 -= l.z * x34; x43 -= l.w * x35; } { const v4f l = GDN_L4(43, 9); x43 -= l.x * x36; x43 -= l.y * x37; x43 -= l.z * x38; x43 -= l.w * x39; } { const v4f l = GDN_L4(43, 10); x43 -= l.x * x40; x43 -= l.y * x41; x43 -= l.z * x42; } __builtin_amdgcn_sched_barrier(0);
        float x44 = GDN_RHS(44); { const v4f l = GDN_L4(44, 0); x44 -= l.x * x0; x44 -= l.y * x1; x44 -= l.z * x2; x44 -= l.w * x3; } { const v4f l = GDN_L4(44, 1); x44 -= l.x * x4; x44 -= l.y * x5; x44 -= l.z * x6; x44 -= l.w * x7; } { const v4f l = GDN_L4(44, 2); x44 -= l.x * x8; x44 -= l.y * x9; x44 -= l.z * x10; x44 -= l.w * x11; } { const v4f l = GDN_L4(44, 3); x44 -= l.x * x12; x44 -= l.y * x13; x44 -= l.z * x14; x44 -= l.w * x15; } { const v4f l = GDN_L4(44, 4); x44 -= l.x * x16; x44 -= l.y * x17; x44 -= l.z * x18; x44 -= l.w * x19; } { const v4f l = GDN_L4(44, 5); x44 -= l.x * x20; x44 -= l.y * x21; x44 -= l.z * x22; x44 -= l.w * x23; } { const v4f l = GDN_L4(44, 6); x44 -= l.x * x24; x44 -= l.y * x25; x44 -= l.z * x26; x44 -= l.w * x27; } { const v4f l = GDN_L4(44, 7); x44 -= l.x * x28; x44 -= l.y * x29; x44 -= l.z * x30; x44 -= l.w * x31; } { const v4f l = GDN_L4(44, 8); x44 -= l.x * x32; x44 -= l.y * x33; x44 -= l.z * x34; x44 -= l.w * x35; } { const v4f l = GDN_L4(44, 9); x44 -= l.x * x36; x44 -= l.y * x37; x44 -= l.z * x38; x44 -= l.w * x39; } { const v4f l = GDN_L4(44, 10); x44 -= l.x * x40; x44 -= l.y * x41; x44 -= l.z * x42; x44 -= l.w * x43; } __builtin_amdgcn_sched_barrier(0);
        float x45 = GDN_RHS(45); { const v4f l = GDN_L4(45, 0); x45 -= l.x * x0; x45 -= l.y * x1; x45 -= l.z * x2; x45 -= l.w * x3; } { const v4f l = GDN_L4(45, 1); x45 -= l.x * x4; x45 -= l.y * x5; x45 -= l.z * x6; x45 -= l.w * x7; } { const v4f l = GDN_L4(45, 2); x45 -= l.x * x8; x45 -= l.y * x9; x45 -= l.z * x10; x45 -= l.w * x11; } { const v4f l = GDN_L4(45, 3); x45 -= l.x * x12; x45 -= l.y * x13; x45 -= l.z * x14; x45 -= l.w * x15; } { const v4f l = GDN_L4(45, 4); x45 -= l.x * x16; x45 -= l.y * x17; x45 -= l.z * x18; x45 -= l.w * x19; } { const v4f l = GDN_L4(45, 5); x45 -= l.x * x20; x45 -= l.y * x21; x45 -= l.z * x22; x45 -= l.w * x23; } { const v4f l = GDN_L4(45, 6); x45 -= l.x * x24; x45 -= l.y * x25; x45 -= l.z * x26; x45 -= l.w * x27; } { const v4f l = GDN_L4(45, 7); x45 -= l.x * x28; x45 -= l.y * x29; x45 -= l.z * x30; x45 -= l.w * x31; } { const v4f l = GDN_L4(45, 8); x45 -= l.x * x32; x45 -= l.y * x33; x45 -= l.z * x34; x45 -= l.w * x35; } { const v4f l = GDN_L4(45, 9); x45 -= l.x * x36; x45 -= l.y * x37; x45 -= l.z * x38; x45 -= l.w * x39; } { const v4f l = GDN_L4(45, 10); x45 -= l.x * x40; x45 -= l.y * x41; x45 -= l.z * x42; x45 -= l.w * x43; } { const v4f l = GDN_L4(45, 11); x45 -= l.x * x44; } __builtin_amdgcn_sched_barrier(0);
        float x46 = GDN_RHS(46); { const v4f l = GDN_L4(46, 0); x46 -= l.x * x0; x46 -= l.y * x1; x46 -= l.z * x2; x46 -= l.w * x3; } { const v4f l = GDN_L4(46, 1); x46 -= l.x * x4; x46 -= l.y * x5; x46 -= l.z * x6; x46 -= l.w * x7; } { const v4f l = GDN_L4(46, 2); x46 -= l.x * x8; x46 -= l.y * x9; x46 -= l.z * x10; x46 -= l.w * x11; } { const v4f l = GDN_L4(46, 3); x46 -= l.x * x12; x46 -= l.y * x13; x46 -= l.z * x14; x46 -= l.w * x15; } { const v4f l = GDN_L4(46, 4); x46 -= l.x * x16; x46 -= l.y * x17; x46 -= l.z * x18; x46 -= l.w * x19; } { const v4f l = GDN_L4(46, 5); x46 -= l.x * x20; x46 -= l.y * x21; x46 -= l.z * x22; x46 -= l.w * x23; } { const v4f l = GDN_L4(46, 6); x46 -= l.x * x24; x46 -= l.y * x25; x46 -= l.z * x26; x46 -= l.w * x27; } { const v4f l = GDN_L4(46, 7); x46 -= l.x * x28; x46 -= l.y * x29; x46 -= l.z * x30; x46 -= l.w * x31; } { const v4f l = GDN_L4(46, 8); x46 -= l.x * x32; x46 -= l.y * x33; x46 -= l.z * x34; x46 -= l.w * x35; } { const v4f l = GDN_L4(46, 9); x46 -= l.x * x36; x46 -= l.y * x37; x46 -= l.z * x38; x46 -= l.w * x39; } { const v4f l = GDN_L4(46, 10); x46 -= l.x * x40; x46 -= l.y * x41; x46 -= l.z * x42; x46 -= l.w * x43; } { const v4f l = GDN_L4(46, 11); x46 -= l.x * x44; x46 -= l.y * x45; } __builtin_amdgcn_sched_barrier(0);
        float x47 = GDN_RHS(47); { const v4f l = GDN_L4(47, 0); x47 -= l.x * x0; x47 -= l.y * x1; x47 -= l.z * x2; x47 -= l.w * x3; } { const v4f l = GDN_L4(47, 1); x47 -= l.x * x4; x47 -= l.y * x5; x47 -= l.z * x6; x47 -= l.w * x7; } { const v4f l = GDN_L4(47, 2); x47 -= l.x * x8; x47 -= l.y * x9; x47 -= l.z * x10; x47 -= l.w * x11; } { const v4f l = GDN_L4(47, 3); x47 -= l.x * x12; x47 -= l.y * x13; x47 -= l.z * x14; x47 -= l.w * x15; } { const v4f l = GDN_L4(47, 4); x47 -= l.x * x16; x47 -= l.y * x17; x47 -= l.z * x18; x47 -= l.w * x19; } { const v4f l = GDN_L4(47, 5); x47 -= l.x * x20; x47 -= l.y * x21; x47 -= l.z * x22; x47 -= l.w * x23; } { const v4f l = GDN_L4(47, 6); x47 -= l.x * x24; x47 -= l.y * x25; x47 -= l.z * x26; x47 -= l.w * x27; } { const v4f l = GDN_L4(47, 7); x47 -= l.x * x28; x47 -= l.y * x29; x47 -= l.z * x30; x47 -= l.w * x31; } { const v4f l = GDN_L4(47, 8); x47 -= l.x * x32; x47 -= l.y * x33; x47 -= l.z * x34; x47 -= l.w * x35; } { const v4f l = GDN_L4(47, 9); x47 -= l.x * x36; x47 -= l.y * x37; x47 -= l.z * x38; x47 -= l.w * x39; } { const v4f l = GDN_L4(47, 10); x47 -= l.x * x40; x47 -= l.y * x41; x47 -= l.z * x42; x47 -= l.w * x43; } { const v4f l = GDN_L4(47, 11); x47 -= l.x * x44; x47 -= l.y * x45; x47 -= l.z * x46; } __builtin_amdgcn_sched_barrier(0);
        float x48 = GDN_RHS(48); { const v4f l = GDN_L4(48, 0); x48 -= l.x * x0; x48 -= l.y * x1; x48 -= l.z * x2; x48 -= l.w * x3; } { const v4f l = GDN_L4(48, 1); x48 -= l.x * x4; x48 -= l.y * x5; x48 -= l.z * x6; x48 -= l.w * x7; } { const v4f l = GDN_L4(48, 2); x48 -= l.x * x8; x48 -= l.y * x9; x48 -= l.z * x10; x48 -= l.w * x11; } { const v4f l = GDN_L4(48, 3); x48 -= l.x * x12; x48 -= l.y * x13; x48 -= l.z * x14; x48 -= l.w * x15; } { const v4f l = GDN_L4(48, 4); x48 -= l.x * x16; x48 -= l.y * x17; x48 -= l.z * x18; x48 -= l.w * x19; } { const v4f l = GDN_L4(48, 5); x48 -= l.x * x20; x48 -= l.y * x21; x48 -= l.z * x22; x48 -= l.w * x23; } { const v4f l = GDN_L4(48, 6); x48 -= l.x * x24; x48 -= l.y * x25; x48 -= l.z * x26; x48 -= l.w * x27; } { const v4f l = GDN_L4(48, 7); x48 -= l.x * x28; x48 -= l.y * x29; x48 -= l.z * x30; x48 -= l.w * x31; } { const v4f l = GDN_L4(48, 8); x48 -= l.x * x32; x48 -= l.y * x33; x48 -= l.z * x34; x48 -= l.w * x35; } { const v4f l = GDN_L4(48, 9); x48 -= l.x * x36; x48 -= l.y * x37; x48 -= l.z * x38; x48 -= l.w * x39; } { const v4f l = GDN_L4(48, 10); x48 -= l.x * x40; x48 -= l.y * x41; x48 -= l.z * x42; x48 -= l.w * x43; } { const v4f l = GDN_L4(48, 11); x48 -= l.x * x44; x48 -= l.y * x45; x48 -= l.z * x46; x48 -= l.w * x47; } __builtin_amdgcn_sched_barrier(0);
        float x49 = GDN_RHS(49); { const v4f l = GDN_L4(49, 0); x49 -= l.x * x0; x49 -= l.y * x1; x49 -= l.z * x2; x49 -= l.w * x3; } { const v4f l = GDN_L4(49, 1); x49 -= l.x * x4; x49 -= l.y * x5; x49 -= l.z * x6; x49 -= l.w * x7; } { const v4f l = GDN_L4(49, 2); x49 -= l.x * x8; x49 -= l.y * x9; x49 -= l.z * x10; x49 -= l.w * x11; } { const v4f l = GDN_L4(49, 3); x49 -= l.x * x12; x49 -= l.y * x13; x49 -= l.z * x14; x49 -= l.w * x15; } { const v4f l = GDN_L4(49, 4); x49 -= l.x * x16; x49 -= l.y * x17; x49 -= l.z * x18; x49 -= l.w * x19; } { const v4f l = GDN_L4(49, 5); x49 -= l.x * x20; x49 -= l.y * x21; x49 -= l.z * x22; x49 -= l.w * x23; } { const v4f l = GDN_L4(49, 6); x49 -= l.x * x24; x49 -= l.y * x25; x49 -= l.z * x26; x49 -= l.w * x27; } { const v4f l = GDN_L4(49, 7); x49 -= l.x * x28; x49 -= l.y * x29; x49 -= l.z * x30; x49 -= l.w * x31; } { const v4f l = GDN_L4(49, 8); x49 -= l.x * x32; x49 -= l.y * x33; x49 -= l.z * x34; x49 -= l.w * x35; } { const v4f l = GDN_L4(49, 9); x49 -= l.x * x36; x49 -= l.y * x37; x49 -= l.z * x38; x49 -= l.w * x39; } { const v4f l = GDN_L4(49, 10); x49 -= l.x * x40; x49 -= l.y * x41; x49 -= l.z * x42; x49 -= l.w * x43; } { const v4f l = GDN_L4(49, 11); x49 -= l.x * x44; x49 -= l.y * x45; x49 -= l.z * x46; x49 -= l.w * x47; } { const v4f l = GDN_L4(49, 12); x49 -= l.x * x48; } __builtin_amdgcn_sched_barrier(0);
        float x50 = GDN_RHS(50); { const v4f l = GDN_L4(50, 0); x50 -= l.x * x0; x50 -= l.y * x1; x50 -= l.z * x2; x50 -= l.w * x3; } { const v4f l = GDN_L4(50, 1); x50 -= l.x * x4; x50 -= l.y * x5; x50 -= l.z * x6; x50 -= l.w * x7; } { const v4f l = GDN_L4(50, 2); x50 -= l.x * x8; x50 -= l.y * x9; x50 -= l.z * x10; x50 -= l.w * x11; } { const v4f l = GDN_L4(50, 3); x50 -= l.x * x12; x50 -= l.y * x13; x50 -= l.z * x14; x50 -= l.w * x15; } { const v4f l = GDN_L4(50, 4); x50 -= l.x * x16; x50 -= l.y * x17; x50 -= l.z * x18; x50 -= l.w * x19; } { const v4f l = GDN_L4(50, 5); x50 -= l.x * x20; x50 -= l.y * x21; x50 -= l.z * x22; x50 -= l.w * x23; } { const v4f l = GDN_L4(50, 6); x50 -= l.x * x24; x50 -= l.y * x25; x50 -= l.z * x26; x50 -= l.w * x27; } { const v4f l = GDN_L4(50, 7); x50 -= l.x * x28; x50 -= l.y * x29; x50 -= l.z * x30; x50 -= l.w * x31; } { const v4f l = GDN_L4(50, 8); x50 -= l.x * x32; x50 -= l.y * x33; x50 -= l.z * x34; x50 -= l.w * x35; } { const v4f l = GDN_L4(50, 9); x50 -= l.x * x36; x50 -= l.y * x37; x50 -= l.z * x38; x50 -= l.w * x39; } { const v4f l = GDN_L4(50, 10); x50 -= l.x * x40; x50 -= l.y * x41; x50 -= l.z * x42; x50 -= l.w * x43; } { const v4f l = GDN_L4(50, 11); x50 -= l.x * x44; x50 -= l.y * x45; x50 -= l.z * x46; x50 -= l.w * x47; } { const v4f l = GDN_L4(50, 12); x50 -= l.x * x48; x50 -= l.y * x49; } __builtin_amdgcn_sched_barrier(0);
        float x51 = GDN_RHS(51); { const v4f l = GDN_L4(51, 0); x51 -= l.x * x0; x51 -= l.y * x1; x51 -= l.z * x2; x51 -= l.w * x3; } { const v4f l = GDN_L4(51, 1); x51 -= l.x * x4; x51 -= l.y * x5; x51 -= l.z * x6; x51 -= l.w * x7; } { const v4f l = GDN_L4(51, 2); x51 -= l.x * x8; x51 -= l.y * x9; x51 -= l.z * x10; x51 -= l.w * x11; } { const v4f l = GDN_L4(51, 3); x51 -= l.x * x12; x51 -= l.y * x13; x51 -= l.z * x14; x51 -= l.w * x15; } { const v4f l = GDN_L4(51, 4); x51 -= l.x * x16; x51 -= l.y * x17; x51 -= l.z * x18; x51 -= l.w * x19; } { const v4f l = GDN_L4(51, 5); x51 -= l.x * x20; x51 -= l.y * x21; x51 -= l.z * x22; x51 -= l.w * x23; } { const v4f l = GDN_L4(51, 6); x51 -= l.x * x24; x51 -= l.y * x25; x51 -= l.z * x26; x51 -= l.w * x27; } { const v4f l = GDN_L4(51, 7); x51 -= l.x * x28; x51 -= l.y * x29; x51 -= l.z * x30; x51 -= l.w * x31; } { const v4f l = GDN_L4(51, 8); x51 -= l.x * x32; x51 -= l.y * x33; x51 -= l.z * x34; x51 -= l.w * x35; } { const v4f l = GDN_L4(51, 9); x51 -= l.x * x36; x51 -= l.y * x37; x51 -= l.z * x38; x51 -= l.w * x39; } { const v4f l = GDN_L4(51, 10); x51 -= l.x * x40; x51 -= l.y * x41; x51 -= l.z * x42; x51 -= l.w * x43; } { const v4f l = GDN_L4(51, 11); x51 -= l.x * x44; x51 -= l.y * x45; x51 -= l.z * x46; x51 -= l.w * x47; } { const v4f l = GDN_L4(51, 12); x51 -= l.x * x48; x51 -= l.y * x49; x51 -= l.z * x50; } __builtin_amdgcn_sched_barrier(0);
        float x52 = GDN_RHS(52); { const v4f l = GDN_L4(52, 0); x52 -= l.x * x0; x52 -= l.y * x1; x52 -= l.z * x2; x52 -= l.w * x3; } { const v4f l = GDN_L4(52, 1); x52 -= l.x * x4; x52 -= l.y * x5; x52 -= l.z * x6; x52 -= l.w * x7; } { const v4f l = GDN_L4(52, 2); x52 -= l.x * x8; x52 -= l.y * x9; x52 -= l.z * x10; x52 -= l.w * x11; } { const v4f l = GDN_L4(52, 3); x52 -= l.x * x12; x52 -= l.y * x13; x52 -= l.z * x14; x52 -= l.w * x15; } { const v4f l = GDN_L4(52, 4); x52 -= l.x * x16; x52 -= l.y * x17; x52 -= l.z * x18; x52 -= l.w * x19; } { const v4f l = GDN_L4(52, 5); x52 -= l.x * x20; x52 -= l.y * x21; x52 -= l.z * x22; x52 -= l.w * x23; } { const v4f l = GDN_L4(52, 6); x52 -= l.x * x24; x52 -= l.y * x25; x52 -= l.z * x26; x52 -= l.w * x27; } { const v4f l = GDN_L4(52, 7); x52 -= l.x * x28; x52 -= l.y * x29; x52 -= l.z * x30; x52 -= l.w * x31; } { const v4f l = GDN_L4(52, 8); x52 -= l.x * x32; x52 -= l.y * x33; x52 -= l.z * x34; x52 -= l.w * x35; } { const v4f l = GDN_L4(52, 9); x52 -= l.x * x36; x52 -= l.y * x37; x52 -= l.z * x38; x52 -= l.w * x39; } { const v4f l = GDN_L4(52, 10); x52 -= l.x * x40; x52 -= l.y * x41; x52 -= l.z * x42; x52 -= l.w * x43; } { const v4f l = GDN_L4(52, 11); x52 -= l.x * x44; x52 -= l.y * x45; x52 -= l.z * x46; x52 -= l.w * x47; } { const v4f l = GDN_L4(52, 12); x52 -= l.x * x48; x52 -= l.y * x49; x52 -= l.z * x50; x52 -= l.w * x51; } __builtin_amdgcn_sched_barrier(0);
        float x53 = GDN_RHS(53); { const v4f l = GDN_L4(53, 0); x53 -= l.x * x0; x53 -= l.y * x1; x53 -= l.z * x2; x53 -= l.w * x3; } { const v4f l = GDN_L4(53, 1); x53 -= l.x * x4; x53 -= l.y * x5; x53 -= l.z * x6; x53 -= l.w * x7; } { const v4f l = GDN_L4(53, 2); x53 -= l.x * x8; x53 -= l.y * x9; x53 -= l.z * x10; x53 -= l.w * x11; } { const v4f l = GDN_L4(53, 3); x53 -= l.x * x12; x53 -= l.y * x13; x53 -= l.z * x14; x53 -= l.w * x15; } { const v4f l = GDN_L4(53, 4); x53 -= l.x * x16; x53 -= l.y * x17; x53 -= l.z * x18; x53 -= l.w * x19; } { const v4f l = GDN_L4(53, 5); x53 -= l.x * x20; x53 -= l.y * x21; x53 -= l.z * x22; x53 -= l.w * x23; } { const v4f l = GDN_L4(53, 6); x53 -= l.x * x24; x53 -= l.y * x25; x53 -= l.z * x26; x53 -= l.w * x27; } { const v4f l = GDN_L4(53, 7); x53 -= l.x * x28; x53 -= l.y * x29; x53 -= l.z * x30; x53 -= l.w * x31; } { const v4f l = GDN_L4(53, 8); x53 -= l.x * x32; x53 -= l.y * x33; x53 -= l.z * x34; x53 -= l.w * x35; } { const v4f l = GDN_L4(53, 9); x53 -= l.x * x36; x53 -= l.y * x37; x53 -= l.z * x38; x53 -= l.w * x39; } { const v4f l = GDN_L4(53, 10); x53 -= l.x * x40; x53 -= l.y * x41; x53 -= l.z * x42; x53 -= l.w * x43; } { const v4f l = GDN_L4(53, 11); x53 -= l.x * x44; x53 -= l.y * x45; x53 -= l.z * x46; x53 -= l.w * x47; } { const v4f l = GDN_L4(53, 12); x53 -= l.x * x48; x53 -= l.y * x49; x53 -= l.z * x50; x53 -= l.w * x51; } { const v4f l = GDN_L4(53, 13); x53 -= l.x * x52; } __builtin_amdgcn_sched_barrier(0);
        float x54 = GDN_RHS(54); { const v4f l = GDN_L4(54, 0); x54 -= l.x * x0; x54 -= l.y * x1; x54 -= l.z * x2; x54 -= l.w * x3; } { const v4f l = GDN_L4(54, 1); x54 -= l.x * x4; x54 -= l.y * x5; x54 -= l.z * x6; x54 -= l.w * x7; } { const v4f l = GDN_L4(54, 2); x54 -= l.x * x8; x54 -= l.y * x9; x54 -= l.z * x10; x54 -= l.w * x11; } { const v4f l = GDN_L4(54, 3); x54 -= l.x * x12; x54 -= l.y * x13; x54 -= l.z * x14; x54 -= l.w * x15; } { const v4f l = GDN_L4(54, 4); x54 -= l.x * x16; x54 -= l.y * x17; x54 -= l.z * x18; x54 -= l.w * x19; } { const v4f l = GDN_L4(54, 5); x54 -= l.x * x20; x54 -= l.y * x21; x54 -= l.z * x22; x54 -= l.w * x23; } { const v4f l = GDN_L4(54, 6); x54 -= l.x * x24; x54 -= l.y * x25; x54 -= l.z * x26; x54 -= l.w * x27; } { const v4f l = GDN_L4(54, 7); x54 -= l.x * x28; x54 -= l.y * x29; x54 -= l.z * x30; x54 -= l.w * x31; } { const v4f l = GDN_L4(54, 8); x54 -= l.x * x32; x54 -= l.y * x33; x54 -= l.z * x34; x54 -= l.w * x35; } { const v4f l = GDN_L4(54, 9); x54 -= l.x * x36; x54 -= l.y * x37; x54 -= l.z * x38; x54 -= l.w * x39; } { const v4f l = GDN_L4(54, 10); x54 -= l.x * x40; x54 -= l.y * x41; x54 -= l.z * x42; x54 -= l.w * x43; } { const v4f l = GDN_L4(54, 11); x54 -= l.x * x44; x54 -= l.y * x45; x54 -= l.z * x46; x54 -= l.w * x47; } { const v4f l = GDN_L4(54, 12); x54 -= l.x * x48; x54 -= l.y * x49; x54 -= l.z * x50; x54 -= l.w * x51; } { const v4f l = GDN_L4(54, 13); x54 -= l.x * x52; x54 -= l.y * x53; } __builtin_amdgcn_sched_barrier(0);
        float x55 = GDN_RHS(55); { const v4f l = GDN_L4(55, 0); x55 -= l.x * x0; x55 -= l.y * x1; x55 -= l.z * x2; x55 -= l.w * x3; } { const v4f l = GDN_L4(55, 1); x55 -= l.x * x4; x55 -= l.y * x5; x55 -= l.z * x6; x55 -= l.w * x7; } { const v4f l = GDN_L4(55, 2); x55 -= l.x * x8; x55 -= l.y * x9; x55 -= l.z * x10; x55 -= l.w * x11; } { const v4f l = GDN_L4(55, 3); x55 -= l.x * x12; x55 -= l.y * x13; x55 -= l.z * x14; x55 -= l.w * x15; } { const v4f l = GDN_L4(55, 4); x55 -= l.x * x16; x55 -= l.y * x17; x55 -= l.z * x18; x55 -= l.w * x19; } { const v4f l = GDN_L4(55, 5); x55 -= l.x * x20; x55 -= l.y * x21; x55 -= l.z * x22; x55 -= l.w * x23; } { const v4f l = GDN_L4(55, 6); x55 -= l.x * x24; x55 -= l.y * x25; x55 -= l.z * x26; x55 -= l.w * x27; } { const v4f l = GDN_L4(55, 7); x55 -= l.x * x28; x55 -= l.y * x29; x55 -= l.z * x30; x55 -= l.w * x31; } { const v4f l = GDN_L4(55, 8); x55 -= l.x * x32; x55 -= l.y * x33; x55 -= l.z * x34; x55 -= l.w * x35; } { const v4f l = GDN_L4(55, 9); x55 -= l.x * x36; x55 -= l.y * x37; x55 -= l.z * x38; x55 -= l.w * x39; } { const v4f l = GDN_L4(55, 10); x55 -= l.x * x40; x55 -= l.y * x41; x55 -= l.z * x42; x55 -= l.w * x43; } { const v4f l = GDN_L4(55, 11); x55 -= l.x * x44; x55 -= l.y * x45; x55 -= l.z * x46; x55 -= l.w * x47; } { const v4f l = GDN_L4(55, 12); x55 -= l.x * x48; x55 -= l.y * x49; x55 -= l.z * x50; x55 -= l.w * x51; } { const v4f l = GDN_L4(55, 13); x55 -= l.x * x52; x55 -= l.y * x53; x55 -= l.z * x54; } __builtin_amdgcn_sched_barrier(0);
        float x56 = GDN_RHS(56); { const v4f l = GDN_L4(56, 0); x56 -= l.x * x0; x56 -= l.y * x1; x56 -= l.z * x2; x56 -= l.w * x3; } { const v4f l = GDN_L4(56, 1); x56 -= l.x * x4; x56 -= l.y * x5; x56 -= l.z * x6; x56 -= l.w * x7; } { const v4f l = GDN_L4(56, 2); x56 -= l.x * x8; x56 -= l.y * x9; x56 -= l.z * x10; x56 -= l.w * x11; } { const v4f l = GDN_L4(56, 3); x56 -= l.x * x12; x56 -= l.y * x13; x56 -= l.z * x14; x56 -= l.w * x15; } { const v4f l = GDN_L4(56, 4); x56 -= l.x * x16; x56 -= l.y * x17; x56 -= l.z * x18; x56 -= l.w * x19; } { const v4f l = GDN_L4(56, 5); x56 -= l.x * x20; x56 -= l.y * x21; x56 -= l.z * x22; x56 -= l.w * x23; } { const v4f l = GDN_L4(56, 6); x56 -= l.x * x24; x56 -= l.y * x25; x56 -= l.z * x26; x56 -= l.w * x27; } { const v4f l = GDN_L4(56, 7); x56 -= l.x * x28; x56 -= l.y * x29; x56 -= l.z * x30; x56 -= l.w * x31; } { const v4f l = GDN_L4(56, 8); x56 -= l.x * x32; x56 -= l.y * x33; x56 -= l.z * x34; x56 -= l.w * x35; } { const v4f l = GDN_L4(56, 9); x56 -= l.x * x36; x56 -= l.y * x37; x56 -= l.z * x38; x56 -= l.w * x39; } { const v4f l = GDN_L4(56, 10); x56 -= l.x * x40; x56 -= l.y * x41; x56 -= l.z * x42; x56 -= l.w * x43; } { const v4f l = GDN_L4(56, 11); x56 -= l.x * x44; x56 -= l.y * x45; x56 -= l.z * x46; x56 -= l.w * x47; } { const v4f l = GDN_L4(56, 12); x56 -= l.x * x48; x56 -= l.y * x49; x56 -= l.z * x50; x56 -= l.w * x51; } { const v4f l = GDN_L4(56, 13); x56 -= l.x * x52; x56 -= l.y * x53; x56 -= l.z * x54; x56 -= l.w * x55; } __builtin_amdgcn_sched_barrier(0);
        float x57 = GDN_RHS(57); { const v4f l = GDN_L4(57, 0); x57 -= l.x * x0; x57 -= l.y * x1; x57 -= l.z * x2; x57 -= l.w * x3; } { const v4f l = GDN_L4(57, 1); x57 -= l.x * x4; x57 -= l.y * x5; x57 -= l.z * x6; x57 -= l.w * x7; } { const v4f l = GDN_L4(57, 2); x57 -= l.x * x8; x57 -= l.y * x9; x57 -= l.z * x10; x57 -= l.w * x11; } { const v4f l = GDN_L4(57, 3); x57 -= l.x * x12; x57 -= l.y * x13; x57 -= l.z * x14; x57 -= l.w * x15; } { const v4f l = GDN_L4(57, 4); x57 -= l.x * x16; x57 -= l.y * x17; x57 -= l.z * x18; x57 -= l.w * x19; } { const v4f l = GDN_L4(57, 5); x57 -= l.x * x20; x57 -= l.y * x21; x57 -= l.z * x22; x57 -= l.w * x23; } { const v4f l = GDN_L4(57, 6); x57 -= l.x * x24; x57 -= l.y * x25; x57 -= l.z * x26; x57 -= l.w * x27; } { const v4f l = GDN_L4(57, 7); x57 -= l.x * x28; x57 -= l.y * x29; x57 -= l.z * x30; x57 -= l.w * x31; } { const v4f l = GDN_L4(57, 8); x57 -= l.x * x32; x57 -= l.y * x33; x57 -= l.z * x34; x57 -= l.w * x35; } { const v4f l = GDN_L4(57, 9); x57 -= l.x * x36; x57 -= l.y * x37; x57 -= l.z * x38; x57 -= l.w * x39; } { const v4f l = GDN_L4(57, 10); x57 -= l.x * x40; x57 -= l.y * x41; x57 -= l.z * x42; x57 -= l.w * x43; } { const v4f l = GDN_L4(57, 11); x57 -= l.x * x44; x57 -= l.y * x45; x57 -= l.z * x46; x57 -= l.w * x47; } { const v4f l = GDN_L4(57, 12); x57 -= l.x * x48; x57 -= l.y * x49; x57 -= l.z * x50; x57 -= l.w * x51; } { const v4f l = GDN_L4(57, 13); x57 -= l.x * x52; x57 -= l.y * x53; x57 -= l.z * x54; x57 -= l.w * x55; } { const v4f l = GDN_L4(57, 14); x57 -= l.x * x56; } __builtin_amdgcn_sched_barrier(0);
        float x58 = GDN_RHS(58); { const v4f l = GDN_L4(58, 0); x58 -= l.x * x0; x58 -= l.y * x1; x58 -= l.z * x2; x58 -= l.w * x3; } { const v4f l = GDN_L4(58, 1); x58 -= l.x * x4; x58 -= l.y * x5; x58 -= l.z * x6; x58 -= l.w * x7; } { const v4f l = GDN_L4(58, 2); x58 -= l.x * x8; x58 -= l.y * x9; x58 -= l.z * x10; x58 -= l.w * x11; } { const v4f l = GDN_L4(58, 3); x58 -= l.x * x12; x58 -= l.y * x13; x58 -= l.z * x14; x58 -= l.w * x15; } { const v4f l = GDN_L4(58, 4); x58 -= l.x * x16; x58 -= l.y * x17; x58 -= l.z * x18; x58 -= l.w * x19; } { const v4f l = GDN_L4(58, 5); x58 -= l.x * x20; x58 -= l.y * x21; x58 -= l.z * x22; x58 -= l.w * x23; } { const v4f l = GDN_L4(58, 6); x58 -= l.x * x24; x58 -= l.y * x25; x58 -= l.z * x26; x58 -= l.w * x27; } { const v4f l = GDN_L4(58, 7); x58 -= l.x * x28; x58 -= l.y * x29; x58 -= l.z * x30; x58 -= l.w * x31; } { const v4f l = GDN_L4(58, 8); x58 -= l.x * x32; x58 -= l.y * x33; x58 -= l.z * x34; x58 -= l.w * x35; } { const v4f l = GDN_L4(58, 9); x58 -= l.x * x36; x58 -= l.y * x37; x58 -= l.z * x38; x58 -= l.w * x39; } { const v4f l = GDN_L4(58, 10); x58 -= l.x * x40; x58 -= l.y * x41; x58 -= l.z * x42; x58 -= l.w * x43; } { const v4f l = GDN_L4(58, 11); x58 -= l.x * x44; x58 -= l.y * x45; x58 -= l.z * x46; x58 -= l.w * x47; } { const v4f l = GDN_L4(58, 12); x58 -= l.x * x48; x58 -= l.y * x49; x58 -= l.z * x50; x58 -= l.w * x51; } { const v4f l = GDN_L4(58, 13); x58 -= l.x * x52; x58 -= l.y * x53; x58 -= l.z * x54; x58 -= l.w * x55; } { const v4f l = GDN_L4(58, 14); x58 -= l.x * x56; x58 -= l.y * x57; } __builtin_amdgcn_sched_barrier(0);
        float x59 = GDN_RHS(59); { const v4f l = GDN_L4(59, 0); x59 -= l.x * x0; x59 -= l.y * x1; x59 -= l.z * x2; x59 -= l.w * x3; } { const v4f l = GDN_L4(59, 1); x59 -= l.x * x4; x59 -= l.y * x5; x59 -= l.z * x6; x59 -= l.w * x7; } { const v4f l = GDN_L4(59, 2); x59 -= l.x * x8; x59 -= l.y * x9; x59 -= l.z * x10; x59 -= l.w * x11; } { const v4f l = GDN_L4(59, 3); x59 -= l.x * x12; x59 -= l.y * x13; x59 -= l.z * x14; x59 -= l.w * x15; } { const v4f l = GDN_L4(59, 4); x59 -= l.x * x16; x59 -= l.y * x17; x59 -= l.z * x18; x59 -= l.w * x19; } { const v4f l = GDN_L4(59, 5); x59 -= l.x * x20; x59 -= l.y * x21; x59 -= l.z * x22; x59 -= l.w * x23; } { const v4f l = GDN_L4(59, 6); x59 -= l.x * x24; x59 -= l.y * x25; x59 -= l.z * x26; x59 -= l.w * x27; } { const v4f l = GDN_L4(59, 7); x59 -= l.x * x28; x59 -= l.y * x29; x59 -= l.z * x30; x59 -= l.w * x31; } { const v4f l = GDN_L4(59, 8); x59 -= l.x * x32; x59 -= l.y * x33; x59 -= l.z * x34; x59 -= l.w * x35; } { const v4f l = GDN_L4(59, 9); x59 -= l.x * x36; x59 -= l.y * x37; x59 -= l.z * x38; x59 -= l.w * x39; } { const v4f l = GDN_L4(59, 10); x59 -= l.x * x40; x59 -= l.y * x41; x59 -= l.z * x42; x59 -= l.w * x43; } { const v4f l = GDN_L4(59, 11); x59 -= l.x * x44; x59 -= l.y * x45; x59 -= l.z * x46; x59 -= l.w * x47; } { const v4f l = GDN_L4(59, 12); x59 -= l.x * x48; x59 -= l.y * x49; x59 -= l.z * x50; x59 -= l.w * x51; } { const v4f l = GDN_L4(59, 13); x59 -= l.x * x52; x59 -= l.y * x53; x59 -= l.z * x54; x59 -= l.w * x55; } { const v4f l = GDN_L4(59, 14); x59 -= l.x * x56; x59 -= l.y * x57; x59 -= l.z * x58; } __builtin_amdgcn_sched_barrier(0);
        float x60 = GDN_RHS(60); { const v4f l = GDN_L4(60, 0); x60 -= l.x * x0; x60 -= l.y * x1; x60 -= l.z * x2; x60 -= l.w * x3; } { const v4f l = GDN_L4(60, 1); x60 -= l.x * x4; x60 -= l.y * x5; x60 -= l.z * x6; x60 -= l.w * x7; } { const v4f l = GDN_L4(60, 2); x60 -= l.x * x8; x60 -= l.y * x9; x60 -= l.z * x10; x60 -= l.w * x11; } { const v4f l = GDN_L4(60, 3); x60 -= l.x * x12; x60 -= l.y * x13; x60 -= l.z * x14; x60 -= l.w * x15; } { const v4f l = GDN_L4(60, 4); x60 -= l.x * x16; x60 -= l.y * x17; x60 -= l.z * x18; x60 -= l.w * x19; } { const v4f l = GDN_L4(60, 5); x60 -= l.x * x20; x60 -= l.y * x21; x60 -= l.z * x22; x60 -= l.w * x23; } { const v4f l = GDN_L4(60, 6); x60 -= l.x * x24; x60 -= l.y * x25; x60 -= l.z * x26; x60 -= l.w * x27; } { const v4f l = GDN_L4(60, 7); x60 -= l.x * x28; x60 -= l.y * x29; x60 -= l.z * x30; x60 -= l.w * x31; } { const v4f l = GDN_L4(60, 8); x60 -= l.x * x32; x60 -= l.y * x33; x60 -= l.z * x34; x60 -= l.w * x35; } { const v4f l = GDN_L4(60, 9); x60 -= l.x * x36; x60 -= l.y * x37; x60 -= l.z * x38; x60 -= l.w * x39; } { const v4f l = GDN_L4(60, 10); x60 -= l.x * x40; x60 -= l.y * x41; x60 -= l.z * x42; x60 -= l.w * x43; } { const v4f l = GDN_L4(60, 11); x60 -= l.x * x44; x60 -= l.y * x45; x60 -= l.z * x46; x60 -= l.w * x47; } { const v4f l = GDN_L4(60, 12); x60 -= l.x * x48; x60 -= l.y * x49; x60 -= l.z * x50; x60 -= l.w * x51; } { const v4f l = GDN_L4(60, 13); x60 -= l.x * x52; x60 -= l.y * x53; x60 -= l.z * x54; x60 -= l.w * x55; } { const v4f l = GDN_L4(60, 14); x60 -= l.x * x56; x60 -= l.y * x57; x60 -= l.z * x58; x60 -= l.w * x59; } __builtin_amdgcn_sched_barrier(0);
        float x61 = GDN_RHS(61); { const v4f l = GDN_L4(61, 0); x61 -= l.x * x0; x61 -= l.y * x1; x61 -= l.z * x2; x61 -= l.w * x3; } { const v4f l = GDN_L4(61, 1); x61 -= l.x * x4; x61 -= l.y * x5; x61 -= l.z * x6; x61 -= l.w * x7; } { const v4f l = GDN_L4(61, 2); x61 -= l.x * x8; x61 -= l.y * x9; x61 -= l.z * x10; x61 -= l.w * x11; } { const v4f l = GDN_L4(61, 3); x61 -= l.x * x12; x61 -= l.y * x13; x61 -= l.z * x14; x61 -= l.w * x15; } { const v4f l = GDN_L4(61, 4); x61 -= l.x * x16; x61 -= l.y * x17; x61 -= l.z * x18; x61 -= l.w * x19; } { const v4f l = GDN_L4(61, 5); x61 -= l.x * x20; x61 -= l.y * x21; x61 -= l.z * x22; x61 -= l.w * x23; } { const v4f l = GDN_L4(61, 6); x61 -= l.x * x24; x61 -= l.y * x25; x61 -= l.z * x26; x61 -= l.w * x27; } { const v4f l = GDN_L4(61, 7); x61 -= l.x * x28; x61 -= l.y * x29; x61 -= l.z * x30; x61 -= l.w * x31; } { const v4f l = GDN_L4(61, 8); x61 -= l.x * x32; x61 -= l.y * x33; x61 -= l.z * x34; x61 -= l.w * x35; } { const v4f l = GDN_L4(61, 9); x61 -= l.x * x36; x61 -= l.y * x37; x61 -= l.z * x38; x61 -= l.w * x39; } { const v4f l = GDN_L4(61, 10); x61 -= l.x * x40; x61 -= l.y * x41; x61 -= l.z * x42; x61 -= l.w * x43; } { const v4f l = GDN_L4(61, 11); x61 -= l.x * x44; x61 -= l.y * x45; x61 -= l.z * x46; x61 -= l.w * x47; } { const v4f l = GDN_L4(61, 12); x61 -= l.x * x48; x61 -= l.y * x49; x61 -= l.z * x50; x61 -= l.w * x51; } { const v4f l = GDN_L4(61, 13); x61 -= l.x * x52; x61 -= l.y * x53; x61 -= l.z * x54; x61 -= l.w * x55; } { const v4f l = GDN_L4(61, 14); x61 -= l.x * x56; x61 -= l.y * x57; x61 -= l.z * x58; x61 -= l.w * x59; } { const v4f l = GDN_L4(61, 15); x61 -= l.x * x60; } __builtin_amdgcn_sched_barrier(0);
        float x62 = GDN_RHS(62); { const v4f l = GDN_L4(62, 0); x62 -= l.x * x0; x62 -= l.y * x1; x62 -= l.z * x2; x62 -= l.w * x3; } { const v4f l = GDN_L4(62, 1); x62 -= l.x * x4; x62 -= l.y * x5; x62 -= l.z * x6; x62 -= l.w * x7; } { const v4f l = GDN_L4(62, 2); x62 -= l.x * x8; x62 -= l.y * x9; x62 -= l.z * x10; x62 -= l.w * x11; } { const v4f l = GDN_L4(62, 3); x62 -= l.x * x12; x62 -= l.y * x13; x62 -= l.z * x14; x62 -= l.w * x15; } { const v4f l = GDN_L4(62, 4); x62 -= l.x * x16; x62 -= l.y * x17; x62 -= l.z * x18; x62 -= l.w * x19; } { const v4f l = GDN_L4(62, 5); x62 -= l.x * x20; x62 -= l.y * x21; x62 -= l.z * x22; x62 -= l.w * x23; } { const v4f l = GDN_L4(62, 6); x62 -= l.x * x24; x62 -= l.y * x25; x62 -= l.z * x26; x62 -= l.w * x27; } { const v4f l = GDN_L4(62, 7); x62 -= l.x * x28; x62 -= l.y * x29; x62 -= l.z * x30; x62 -= l.w * x31; } { const v4f l = GDN_L4(62, 8); x62 -= l.x * x32; x62 -= l.y * x33; x62 -= l.z * x34; x62 -= l.w * x35; } { const v4f l = GDN_L4(62, 9); x62 -= l.x * x36; x62 -= l.y * x37; x62 -= l.z * x38; x62 -= l.w * x39; } { const v4f l = GDN_L4(62, 10); x62 -= l.x * x40; x62 -= l.y * x41; x62 -= l.z * x42; x62 -= l.w * x43; } { const v4f l = GDN_L4(62, 11); x62 -= l.x * x44; x62 -= l.y * x45; x62 -= l.z * x46; x62 -= l.w * x47; } { const v4f l = GDN_L4(62, 12); x62 -= l.x * x48; x62 -= l.y * x49; x62 -= l.z * x50; x62 -= l.w * x51; } { const v4f l = GDN_L4(62, 13); x62 -= l.x * x52; x62 -= l.y * x53; x62 -= l.z * x54; x62 -= l.w * x55; } { const v4f l = GDN_L4(62, 14); x62 -= l.x * x56; x62 -= l.y * x57; x62 -= l.z * x58; x62 -= l.w * x59; } { const v4f l = GDN_L4(62, 15); x62 -= l.x * x60; x62 -= l.y * x61; } __builtin_amdgcn_sched_barrier(0);
        float x63 = GDN_RHS(63); { const v4f l = GDN_L4(63, 0); x63 -= l.x * x0; x63 -= l.y * x1; x63 -= l.z * x2; x63 -= l.w * x3; } { const v4f l = GDN_L4(63, 1); x63 -= l.x * x4; x63 -= l.y * x5; x63 -= l.z * x6; x63 -= l.w * x7; } { const v4f l = GDN_L4(63, 2); x63 -= l.x * x8; x63 -= l.y * x9; x63 -= l.z * x10; x63 -= l.w * x11; } { const v4f l = GDN_L4(63, 3); x63 -= l.x * x12; x63 -= l.y * x13; x63 -= l.z * x14; x63 -= l.w * x15; } { const v4f l = GDN_L4(63, 4); x63 -= l.x * x16; x63 -= l.y * x17; x63 -= l.z * x18; x63 -= l.w * x19; } { const v4f l = GDN_L4(63, 5); x63 -= l.x * x20; x63 -= l.y * x21; x63 -= l.z * x22; x63 -= l.w * x23; } { const v4f l = GDN_L4(63, 6); x63 -= l.x * x24; x63 -= l.y * x25; x63 -= l.z * x26; x63 -= l.w * x27; } { const v4f l = GDN_L4(63, 7); x63 -= l.x * x28; x63 -= l.y * x29; x63 -= l.z * x30; x63 -= l.w * x31; } { const v4f l = GDN_L4(63, 8); x63 -= l.x * x32; x63 -= l.y * x33; x63 -= l.z * x34; x63 -= l.w * x35; } { const v4f l = GDN_L4(63, 9); x63 -= l.x * x36; x63 -= l.y * x37; x63 -= l.z * x38; x63 -= l.w * x39; } { const v4f l = GDN_L4(63, 10); x63 -= l.x * x40; x63 -= l.y * x41; x63 -= l.z * x42; x63 -= l.w * x43; } { const v4f l = GDN_L4(63, 11); x63 -= l.x * x44; x63 -= l.y * x45; x63 -= l.z * x46; x63 -= l.w * x47; } { const v4f l = GDN_L4(63, 12); x63 -= l.x * x48; x63 -= l.y * x49; x63 -= l.z * x50; x63 -= l.w * x51; } { const v4f l = GDN_L4(63, 13); x63 -= l.x * x52; x63 -= l.y * x53; x63 -= l.z * x54; x63 -= l.w * x55; } { const v4f l = GDN_L4(63, 14); x63 -= l.x * x56; x63 -= l.y * x57; x63 -= l.z * x58; x63 -= l.w * x59; } { const v4f l = GDN_L4(63, 15); x63 -= l.x * x60; x63 -= l.y * x61; x63 -= l.z * x62; } __builtin_amdgcn_sched_barrier(0);
        if (c < 128) { GU[0 * 128 + c] = x0; GU[1 * 128 + c] = x1; GU[2 * 128 + c] = x2; GU[3 * 128 + c] = x3; GU[4 * 128 + c] = x4; GU[5 * 128 + c] = x5; GU[6 * 128 + c] = x6; GU[7 * 128 + c] = x7; GU[8 * 128 + c] = x8; GU[9 * 128 + c] = x9; GU[10 * 128 + c] = x10; GU[11 * 128 + c] = x11; GU[12 * 128 + c] = x12; GU[13 * 128 + c] = x13; GU[14 * 128 + c] = x14; GU[15 * 128 + c] = x15; GU[16 * 128 + c] = x16; GU[17 * 128 + c] = x17; GU[18 * 128 + c] = x18; GU[19 * 128 + c] = x19; GU[20 * 128 + c] = x20; GU[21 * 128 + c] = x21; GU[22 * 128 + c] = x22; GU[23 * 128 + c] = x23; GU[24 * 128 + c] = x24; GU[25 * 128 + c] = x25; GU[26 * 128 + c] = x26; GU[27 * 128 + c] = x27; GU[28 * 128 + c] = x28; GU[29 * 128 + c] = x29; GU[30 * 128 + c] = x30; GU[31 * 128 + c] = x31; GU[32 * 128 + c] = x32; GU[33 * 128 + c] = x33; GU[34 * 128 + c] = x34; GU[35 * 128 + c] = x35; GU[36 * 128 + c] = x36; GU[37 * 128 + c] = x37; GU[38 * 128 + c] = x38; GU[39 * 128 + c] = x39; GU[40 * 128 + c] = x40; GU[41 * 128 + c] = x41; GU[42 * 128 + c] = x42; GU[43 * 128 + c] = x43; GU[44 * 128 + c] = x44; GU[45 * 128 + c] = x45; GU[46 * 128 + c] = x46; GU[47 * 128 + c] = x47; GU[48 * 128 + c] = x48; GU[49 * 128 + c] = x49; GU[50 * 128 + c] = x50; GU[51 * 128 + c] = x51; GU[52 * 128 + c] = x52; GU[53 * 128 + c] = x53; GU[54 * 128 + c] = x54; GU[55 * 128 + c] = x55; GU[56 * 128 + c] = x56; GU[57 * 128 + c] = x57; GU[58 * 128 + c] = x58; GU[59 * 128 + c] = x59; GU[60 * 128 + c] = x60; GU[61 * 128 + c] = x61; GU[62 * 128 + c] = x62; GU[63 * 128 + c] = x63; }
        else { GNW[0 * 128 + (c - 128)] = (bf16)f2bf(-x0); GNW[1 * 128 + (c - 128)] = (bf16)f2bf(-x1); GNW[2 * 128 + (c - 128)] = (bf16)f2bf(-x2); GNW[3 * 128 + (c - 128)] = (bf16)f2bf(-x3); GNW[4 * 128 + (c - 128)] = (bf16)f2bf(-x4); GNW[5 * 128 + (c - 128)] = (bf16)f2bf(-x5); GNW[6 * 128 + (c - 128)] = (bf16)f2bf(-x6); GNW[7 * 128 + (c - 128)] = (bf16)f2bf(-x7); GNW[8 * 128 + (c - 128)] = (bf16)f2bf(-x8); GNW[9 * 128 + (c - 128)] = (bf16)f2bf(-x9); GNW[10 * 128 + (c - 128)] = (bf16)f2bf(-x10); GNW[11 * 128 + (c - 128)] = (bf16)f2bf(-x11); GNW[12 * 128 + (c - 128)] = (bf16)f2bf(-x12); GNW[13 * 128 + (c - 128)] = (bf16)f2bf(-x13); GNW[14 * 128 + (c - 128)] = (bf16)f2bf(-x14); GNW[15 * 128 + (c - 128)] = (bf16)f2bf(-x15); GNW[16 * 128 + (c - 128)] = (bf16)f2bf(-x16); GNW[17 * 128 + (c - 128)] = (bf16)f2bf(-x17); GNW[18 * 128 + (c - 128)] = (bf16)f2bf(-x18); GNW[19 * 128 + (c - 128)] = (bf16)f2bf(-x19); GNW[20 * 128 + (c - 128)] = (bf16)f2bf(-x20); GNW[21 * 128 + (c - 128)] = (bf16)f2bf(-x21); GNW[22 * 128 + (c - 128)] = (bf16)f2bf(-x22); GNW[23 * 128 + (c - 128)] = (bf16)f2bf(-x23); GNW[24 * 128 + (c - 128)] = (bf16)f2bf(-x24); GNW[25 * 128 + (c - 128)] = (bf16)f2bf(-x25); GNW[26 * 128 + (c - 128)] = (bf16)f2bf(-x26); GNW[27 * 128 + (c - 128)] = (bf16)f2bf(-x27); GNW[28 * 128 + (c - 128)] = (bf16)f2bf(-x28); GNW[29 * 128 + (c - 128)] = (bf16)f2bf(-x29); GNW[30 * 128 + (c - 128)] = (bf16)f2bf(-x30); GNW[31 * 128 + (c - 128)] = (bf16)f2bf(-x31); GNW[32 * 128 + (c - 128)] = (bf16)f2bf(-x32); GNW[33 * 128 + (c - 128)] = (bf16)f2bf(-x33); GNW[34 * 128 + (c - 128)] = (bf16)f2bf(-x34); GNW[35 * 128 + (c - 128)] = (bf16)f2bf(-x35); GNW[36 * 128 + (c - 128)] = (bf16)f2bf(-x36); GNW[37 * 128 + (c - 128)] = (bf16)f2bf(-x37); GNW[38 * 128 + (c - 128)] = (bf16)f2bf(-x38); GNW[39 * 128 + (c - 128)] = (bf16)f2bf(-x39); GNW[40 * 128 + (c - 128)] = (bf16)f2bf(-x40); GNW[41 * 128 + (c - 128)] = (bf16)f2bf(-x41); GNW[42 * 128 + (c - 128)] = (bf16)f2bf(-x42); GNW[43 * 128 + (c - 128)] = (bf16)f2bf(-x43); GNW[44 * 128 + (c - 128)] = (bf16)f2bf(-x44); GNW[45 * 128 + (c - 128)] = (bf16)f2bf(-x45); GNW[46 * 128 + (c - 128)] = (bf16)f2bf(-x46); GNW[47 * 128 + (c - 128)] = (bf16)f2bf(-x47); GNW[48 * 128 + (c - 128)] = (bf16)f2bf(-x48); GNW[49 * 128 + (c - 128)] = (bf16)f2bf(-x49); GNW[50 * 128 + (c - 128)] = (bf16)f2bf(-x50); GNW[51 * 128 + (c - 128)] = (bf16)f2bf(-x51); GNW[52 * 128 + (c - 128)] = (bf16)f2bf(-x52); GNW[53 * 128 + (c - 128)] = (bf16)f2bf(-x53); GNW[54 * 128 + (c - 128)] = (bf16)f2bf(-x54); GNW[55 * 128 + (c - 128)] = (bf16)f2bf(-x55); GNW[56 * 128 + (c - 128)] = (bf16)f2bf(-x56); GNW[57 * 128 + (c - 128)] = (bf16)f2bf(-x57); GNW[58 * 128 + (c - 128)] = (bf16)f2bf(-x58); GNW[59 * 128 + (c - 128)] = (bf16)f2bf(-x59); GNW[60 * 128 + (c - 128)] = (bf16)f2bf(-x60); GNW[61 * 128 + (c - 128)] = (bf16)f2bf(-x61); GNW[62 * 128 + (c - 128)] = (bf16)f2bf(-x62); GNW[63 * 128 + (c - 128)] = (bf16)f2bf(-x63); }
#undef GDN_RHS
#undef GDN_L4
    } else {
        const int t2 = tid - 256; const float gl = gcs[63];
        { const int i = t2 >> 2, d0 = (t2 & 3) * 32; const float e = __expf(gcs[i]);
#pragma unroll
          for (int x8 = 0; x8 < 4; ++x8) { const v4f a = *(const LAS v4f*)(qs + i * QP + d0 + 8 * x8), b = *(const LAS v4f*)(qs + i * QP + d0 + 8 * x8 + 4);
              v4u w; w.x = pk2(a.x * e, a.y * e); w.y = pk2(a.z * e, a.w * e); w.z = pk2(b.x * e, b.y * e); w.w = pk2(b.z * e, b.w * e); *(v4u*)(GQG + i * 128 + d0 + 8 * x8) = w; } }
        { const int d = t2 >> 1, j0 = (t2 & 1) * 32;
#pragma unroll
          for (int x8 = 0; x8 < 4; ++x8) { float o[8];
#pragma unroll
              for (int x = 0; x < 8; ++x) { const int j = j0 + 8 * x8 + x; o[x] = ks[j * QP + d] * __expf(gl - gcs[j]); }
              v4u w; w.x = pk2(o[0], o[1]); w.y = pk2(o[2], o[3]); w.z = pk2(o[4], o[5]); w.w = pk2(o[6], o[7]); *(v4u*)(GKT + d * 64 + j0 + 8 * x8) = w; } }
        if (t2 == 0) GDL[item] = __expf(gl);
    }
    __syncthreads();
}
struct GdnFrags { bf16x8_t nw[4], qg[4], at[2], kt[2][2]; float u[4]; float dl; };
__device__ __forceinline__ void gdn_load(GdnFrags& F, const Params& p, int item, int off128, int off64, int offk, int offu) {
    const bf16* GNW = (const bf16*)(p.ws + WS_GNW) + (size_t)item * 8192; const bf16* GQG = (const bf16*)(p.ws + WS_GQG) + (size_t)item * 8192;
    const bf16* GAT = (const bf16*)(p.ws + WS_GAT) + (size_t)item * 4096; const bf16* GKT = (const bf16*)(p.ws + WS_GKT) + (size_t)item * 8192; const float* GU = (const float*)(p.ws + WS_GU) + (size_t)item * 8192;
#pragma unroll
    for (int ks = 0; ks < 4; ++ks) { F.nw[ks] = *(const bf16x8_t*)(GNW + off128 + 32 * ks); F.qg[ks] = *(const bf16x8_t*)(GQG + off128 + 32 * ks); }
#pragma unroll
    for (int ks = 0; ks < 2; ++ks) { F.at[ks] = *(const bf16x8_t*)(GAT + off64 + 32 * ks); F.kt[0][ks] = *(const bf16x8_t*)(GKT + offk + 32 * ks); F.kt[1][ks] = *(const bf16x8_t*)(GKT + offk + 1024 + 32 * ks); }
#pragma unroll
    for (int r = 0; r < 4; ++r) F.u[r] = GU[offu + r * 128];
    F.dl = ((const float*)(p.ws + WS_GDL))[item];
}
constexpr int STP = 136, VNP = 72;
__device__ __forceinline__ void gdn_seq(const Params& p, LAS unsigned char* lds, int wgi, int wave, int lane) {
    const int u = wgi * 2 + (wave >> 2), wi = wave & 3, h = u >> 3, sl = u & 7, g = lane >> 4, c = lane & 15;
    LAS unsigned short* ST = (LAS unsigned short*)(lds + (wave >> 2) * 12288);
    LAS unsigned short* VNT = ST + 2 * 16 * STP;
    float* GO = (float*)(p.ws + WS_GO);
    const int off128 = (16 * wi + c) * 128 + 8 * g, off64 = (16 * wi + c) * 64 + 8 * g, offk = (32 * wi + c) * 64 + 8 * g, offu = (16 * wi + 4 * g) * 128 + 16 * sl + c;
#pragma unroll
    for (int mt = 0; mt < 2; ++mt) *(LAS v2u*)(ST + c * STP + 16 * (2 * wi + mt) + 4 * g) = (v2u){0u, 0u};
    pg8::f32x4 Sacc[2] = {{0.f, 0.f, 0.f, 0.f}, {0.f, 0.f, 0.f, 0.f}};
    __syncthreads();
    GdnFrags F0, F1;
    gdn_load(F0, p, h, off128, off64, offk, offu);
#define GDN_STEP(F, n_) do { const int cur = (n_) & 1; bf16x8_t sf[4]; \
        _Pragma("unroll") for (int ks = 0; ks < 4; ++ks) sf[ks] = *(const LAS bf16x8_t*)(ST + cur * 16 * STP + c * STP + 32 * ks + 8 * g); \
        pg8::f32x4 vn = {F.u[0], F.u[1], F.u[2], F.u[3]}; \
        _Pragma("unroll") for (int ks = 0; ks < 4; ++ks) vn = __builtin_amdgcn_mfma_f32_16x16x32_bf16(F.nw[ks], sf[ks], vn, 0, 0, 0); \
        { v2u w; w.x = pk2(vn[0], vn[1]); w.y = pk2(vn[2], vn[3]); *(LAS v2u*)(VNT + c * VNP + 16 * wi + 4 * g) = w; } \
        LDS_BAR(); \
        const bf16x8_t v0 = *(const LAS bf16x8_t*)(VNT + c * VNP + 8 * g), v1 = *(const LAS bf16x8_t*)(VNT + c * VNP + 32 + 8 * g); \
        pg8::f32x4 o = {0.f, 0.f, 0.f, 0.f}; \
        _Pragma("unroll") for (int ks = 0; ks < 4; ++ks) o = __builtin_amdgcn_mfma_f32_16x16x32_bf16(F.qg[ks], sf[ks], o, 0, 0, 0); \
        o = __builtin_amdgcn_mfma_f32_16x16x32_bf16(F.at[0], v0, o, 0, 0, 0); o = __builtin_amdgcn_mfma_f32_16x16x32_bf16(F.at[1], v1, o, 0, 0, 0); \
        { const size_t tb = (size_t)(n_) * 64 + 16 * wi + 4 * g; _Pragma("unroll") for (int r = 0; r < 4; ++r) GO[(tb + r) * BW + h * 128 + 16 * sl + c] = o[r]; } \
        _Pragma("unroll") for (int mt = 0; mt < 2; ++mt) { Sacc[mt] = Sacc[mt] * F.dl; \
            Sacc[mt] = __builtin_amdgcn_mfma_f32_16x16x32_bf16(F.kt[mt][0], v0, Sacc[mt], 0, 0, 0); Sacc[mt] = __builtin_amdgcn_mfma_f32_16x16x32_bf16(F.kt[mt][1], v1, Sacc[mt], 0, 0, 0); \
            v2u w; w.x = pk2(Sacc[mt][0], Sacc[mt][1]); w.y = pk2(Sacc[mt][2], Sacc[mt][3]); *(LAS v2u*)(ST + (cur ^ 1) * 16 * STP + c * STP + 16 * (2 * wi + mt) + 4 * g) = w; } \
        LDS_BAR(); } while (0)
    for (int n = 0; n < T / 64; n += 2) {
        gdn_load(F1, p, (n + 1) * 4 + h, off128, off64, offk, offu);
        GDN_STEP(F0, n);
        gdn_load(F0, p, ((n + 2 < T / 64) ? n + 2 : n) * 4 + h, off128, off64, offk, offu);
        GDN_STEP(F1, n + 1);
    }
#undef GDN_STEP
}

constexpr int SEQ_UOFF = 132096;
constexpr int GI_NW = 0, GI_QG = 8704, GI_AT = 17408, GI_KT = 22016, GI_SZ = 31232;
struct GdnStage { v4u r[7]; float u[4]; float dl; };
__device__ __forceinline__ void gdn_stage_load(GdnStage& Sg, const Params& p, int item, int tid, int offu) {
    const bf16* GNW = (const bf16*)(p.ws + WS_GNW) + (size_t)item * 8192; const bf16* GQG = (const bf16*)(p.ws + WS_GQG) + (size_t)item * 8192;
    const bf16* GAT = (const bf16*)(p.ws + WS_GAT) + (size_t)item * 4096; const bf16* GKT = (const bf16*)(p.ws + WS_GKT) + (size_t)item * 8192; const float* GU = (const float*)(p.ws + WS_GU) + (size_t)item * 8192;
    Sg.r[0] = *(const v4u*)(GNW + 8 * tid); Sg.r[1] = *(const v4u*)(GNW + 8 * (tid + 512)); Sg.r[2] = *(const v4u*)(GQG + 8 * tid); Sg.r[3] = *(const v4u*)(GQG + 8 * (tid + 512));
    Sg.r[4] = *(const v4u*)(GAT + 8 * tid); Sg.r[5] = *(const v4u*)(GKT + 8 * tid); Sg.r[6] = *(const v4u*)(GKT + 8 * (tid + 512));
#pragma unroll
    for (int r = 0; r < 4; ++r) Sg.u[r] = GU[offu + r * 128];
    Sg.dl = ((const float*)(p.ws + WS_GDL))[item];
}
__device__ __forceinline__ void gdn_stage_write(const GdnStage& Sg, LAS unsigned short* img, int tid) {
    { const int p0 = tid, p1 = tid + 512;
      *(LAS v4u*)(img + GI_NW + (p0 >> 4) * 136 + 8 * (p0 & 15)) = Sg.r[0]; *(LAS v4u*)(img + GI_NW + (p1 >> 4) * 136 + 8 * (p1 & 15)) = Sg.r[1];
      *(LAS v4u*)(img + GI_QG + (p0 >> 4) * 136 + 8 * (p0 & 15)) = Sg.r[2]; *(LAS v4u*)(img + GI_QG + (p1 >> 4) * 136 + 8 * (p1 & 15)) = Sg.r[3];
      *(LAS v4u*)(img + GI_AT + (p0 >> 3) * 72 + 8 * (p0 & 7)) = Sg.r[4];
      *(LAS v4u*)(img + GI_KT + (p0 >> 3) * 72 + 8 * (p0 & 7)) = Sg.r[5]; *(LAS v4u*)(img + GI_KT + (p1 >> 3) * 72 + 8 * (p1 & 7)) = Sg.r[6]; }
}
__device__ __forceinline__ void gdn_seq2(const Params& p, LAS unsigned char* lds, int wgi, int tid, int wave, int lane) {
    const int h = wgi >> 2, sl = 2 * (wgi & 3) + (wave >> 2), wi = wave & 3, g = lane >> 4, c = lane & 15;
    LAS unsigned short* IMG = (LAS unsigned short*)lds;
    LAS unsigned short* ST = (LAS unsigned short*)(lds + SEQ_UOFF + (wave >> 2) * 12288);
    LAS unsigned short* VNT = ST + 2 * 16 * STP;
    float* GO = (float*)(p.ws + WS_GO);
    const int offu = (16 * wi + 4 * g) * 128 + 16 * sl + c;
#pragma unroll
    for (int mt = 0; mt < 2; ++mt) *(LAS v2u*)(ST + c * STP + 16 * (2 * wi + mt) + 4 * g) = (v2u){0u, 0u};
    pg8::f32x4 Sacc[2] = {{0.f, 0.f, 0.f, 0.f}, {0.f, 0.f, 0.f, 0.f}};
    GdnStage A, B;
    gdn_stage_load(A, p, h, tid, offu); gdn_stage_write(A, IMG, tid);
    gdn_stage_load(B, p, 4 + h, tid, offu);
    LDS_BAR();
    constexpr int NCH = T / 64;
#define GDN_STEP2(X, Y, n_) do { const int cur = (n_) & 1; const LAS unsigned short* im = IMG + cur * GI_SZ; bf16x8_t sf[4]; \
        _Pragma("unroll") for (int ks = 0; ks < 4; ++ks) sf[ks] = *(const LAS bf16x8_t*)(ST + cur * 16 * STP + c * STP + 32 * ks + 8 * g); \
        pg8::f32x4 vn = {X.u[0], X.u[1], X.u[2], X.u[3]}; const float dl = X.dl; \
        _Pragma("unroll") for (int ks = 0; ks < 4; ++ks) vn = __builtin_amdgcn_mfma_f32_16x16x32_bf16(*(const LAS bf16x8_t*)(im + GI_NW + (16 * wi + c) * 136 + 32 * ks + 8 * g), sf[ks], vn, 0, 0, 0); \
        { v2u w; w.x = pk2(vn[0], vn[1]); w.y = pk2(vn[2], vn[3]); *(LAS v2u*)(VNT + c * VNP + 16 * wi + 4 * g) = w; } \
        pg8::f32x4 o = {0.f, 0.f, 0.f, 0.f}; \
        _Pragma("unroll") for (int ks = 0; ks < 4; ++ks) o = __builtin_amdgcn_mfma_f32_16x16x32_bf16(*(const LAS bf16x8_t*)(im + GI_QG + (16 * wi + c) * 136 + 32 * ks + 8 * g), sf[ks], o, 0, 0, 0); \
        LDS_BAR(); \
        gdn_stage_load(X, p, (((n_) + 2 < NCH) ? (n_) + 2 : (n_)) * 4 + h, tid, offu); \
        const bf16x8_t v0 = *(const LAS bf16x8_t*)(VNT + c * VNP + 8 * g), v1 = *(const LAS bf16x8_t*)(VNT + c * VNP + 32 + 8 * g); \
        o = __builtin_amdgcn_mfma_f32_16x16x32_bf16(*(const LAS bf16x8_t*)(im + GI_AT + (16 * wi + c) * 72 + 8 * g), v0, o, 0, 0, 0); \
        o = __builtin_amdgcn_mfma_f32_16x16x32_bf16(*(const LAS bf16x8_t*)(im + GI_AT + (16 * wi + c) * 72 + 32 + 8 * g), v1, o, 0, 0, 0); \
        { const size_t tb = (size_t)(n_) * 64 + 16 * wi + 4 * g; _Pragma("unroll") for (int r = 0; r < 4; ++r) GO[(tb + r) * BW + h * 128 + 16 * sl + c] = o[r]; } \
        _Pragma("unroll") for (int mt = 0; mt < 2; ++mt) { Sacc[mt] = Sacc[mt] * dl; \
            Sacc[mt] = __builtin_amdgcn_mfma_f32_16x16x32_bf16(*(const LAS bf16x8_t*)(im + GI_KT + (16 * (2 * wi + mt) + c) * 72 + 8 * g), v0, Sacc[mt], 0, 0, 0); \
            Sacc[mt] = __builtin_amdgcn_mfma_f32_16x16x32_bf16(*(const LAS bf16x8_t*)(im + GI_KT + (16 * (2 * wi + mt) + c) * 72 + 32 + 8 * g), v1, Sacc[mt], 0, 0, 0); \
            v2u w; w.x = pk2(Sacc[mt][0], Sacc[mt][1]); w.y = pk2(Sacc[mt][2], Sacc[mt][3]); *(LAS v2u*)(ST + (cur ^ 1) * 16 * STP + c * STP + 16 * (2 * wi + mt) + 4 * g) = w; } \
        gdn_stage_write(Y, IMG + (cur ^ 1) * GI_SZ, tid); \
        LDS_BAR(); } while (0)
    for (int n = 0; n < NCH; n += 2) { GDN_STEP2(A, B, n); GDN_STEP2(B, A, n + 1); }
#undef GDN_STEP2
}
constexpr int MI_Q = 0, MI_S = 4608, MI_K = 9216, MI_SZ = 13824;
struct MlStage { v4u r[3]; bf16x8_t vt[2]; float fl; };
__device__ __forceinline__ void ml_stage_load(MlStage& Sg, const Params& p, int item, int tid, int offV) {
    const bf16* MQ = (const bf16*)(p.ws + WS_MQ) + (size_t)item * 4096; const bf16* MS = (const bf16*)(p.ws + WS_MS) + (size_t)item * 4096; const bf16* MK = (const bf16*)(p.ws + WS_MK) + (size_t)item * 4096;
    const bf16* MV = (const bf16*)(p.ws + WS_MV) + (size_t)item * 9216;
    Sg.r[0] = *(const v4u*)(MQ + 8 * tid); Sg.r[1] = *(const v4u*)(MS + 8 * tid); Sg.r[2] = *(const v4u*)(MK + 8 * tid);
    Sg.vt[0] = *(const bf16x8_t*)(MV + offV); Sg.vt[1] = *(const bf16x8_t*)(MV + offV + 32);
    Sg.fl = ((const float*)(p.ws + WS_MFL))[item];
}
__device__ __forceinline__ void ml_stage_write(const MlStage& Sg, LAS unsigned short* img, int tid) {
    const int o = (tid >> 3) * 72 + 8 * (tid & 7);
    *(LAS v4u*)(img + MI_Q + o) = Sg.r[0]; *(LAS v4u*)(img + MI_S + o) = Sg.r[1]; *(LAS v4u*)(img + MI_K + o) = Sg.r[2];
}
__device__ __forceinline__ void ml_seq2(const Params& p, LAS unsigned char* lds, int wgi, int tid, int wave, int lane) {
    const int h = wgi / 5, sl0 = 2 * (wgi % 5) + (wave >> 2), wi = wave & 3, g = lane >> 4, c = lane & 15;
    const bool real = sl0 < 9; const int sl = real ? sl0 : 8;
    LAS unsigned short* IMG = (LAS unsigned short*)lds;
    LAS unsigned short* CT = (LAS unsigned short*)(lds + SEQ_UOFF + (wave >> 2) * 8192);
    float* HO = (float*)(p.ws + WS_HO); float* HDEN = (float*)(p.ws + WS_HDEN);
    const int offV = (16 * sl + c) * 64 + 8 * g;
    *(LAS v2u*)(CT + c * 72 + 16 * wi + 4 * g) = (v2u){0u, 0u};
    pg8::f32x4 Cacc = {0.f, 0.f, 0.f, 0.f};
    MlStage A, B;
    ml_stage_load(A, p, h, tid, offV); ml_stage_write(A, IMG, tid);
    ml_stage_load(B, p, 4 + h, tid, offV);
    LDS_BAR();
    constexpr int NCH = T / 64;
#define ML_STEP2(X, Y, n_) do { const int cur = (n_) & 1; const LAS unsigned short* im = IMG + cur * MI_SZ; const int ro = (16 * wi + c) * 72 + 8 * g; \
        const bf16x8_t c0 = *(const LAS bf16x8_t*)(CT + cur * 16 * 72 + c * 72 + 8 * g), c1 = *(const LAS bf16x8_t*)(CT + cur * 16 * 72 + c * 72 + 32 + 8 * g); \
        const bf16x8_t vt0 = X.vt[0], vt1 = X.vt[1]; const float fl = X.fl; \
        pg8::f32x4 num = {0.f, 0.f, 0.f, 0.f}; \
        num = __builtin_amdgcn_mfma_f32_16x16x32_bf16(*(const LAS bf16x8_t*)(im + MI_Q + ro), c0, num, 0, 0, 0); num = __builtin_amdgcn_mfma_f32_16x16x32_bf16(*(const LAS bf16x8_t*)(im + MI_Q + ro + 32), c1, num, 0, 0, 0); \
        num = __builtin_amdgcn_mfma_f32_16x16x32_bf16(*(const LAS bf16x8_t*)(im + MI_S + ro), vt0, num, 0, 0, 0); num = __builtin_amdgcn_mfma_f32_16x16x32_bf16(*(const LAS bf16x8_t*)(im + MI_S + ro + 32), vt1, num, 0, 0, 0); \
        Cacc = Cacc * fl; \
        Cacc = __builtin_amdgcn_mfma_f32_16x16x32_bf16(*(const LAS bf16x8_t*)(im + MI_K + ro), vt0, Cacc, 0, 0, 0); Cacc = __builtin_amdgcn_mfma_f32_16x16x32_bf16(*(const LAS bf16x8_t*)(im + MI_K + ro + 32), vt1, Cacc, 0, 0, 0); \
        ml_stage_load(X, p, (((n_) + 2 < NCH) ? (n_) + 2 : (n_)) * 4 + h, tid, offV); \
        { v2u w; w.x = pk2(Cacc[0], Cacc[1]); w.y = pk2(Cacc[2], Cacc[3]); *(LAS v2u*)(CT + (cur ^ 1) * 16 * 72 + c * 72 + 16 * wi + 4 * g) = w; } \
        { const size_t tb = (size_t)(n_) * 64 + 16 * wi + 4 * g; \
          if (sl < 8) { _Pragma("unroll") for (int r = 0; r < 4; ++r) HO[(tb + r) * BW + h * 128 + 16 * sl + c] = num[r]; } \
          else if (c == 0 && real) { _Pragma("unroll") for (int r = 0; r < 4; ++r) HDEN[(tb + r) * 4 + h] = num[r]; } } \
        ml_stage_write(Y, IMG + (cur ^ 1) * MI_SZ, tid); \
        LDS_BAR(); } while (0)
    for (int n = 0; n < NCH; n += 2) { ML_STEP2(A, B, n); ML_STEP2(B, A, n + 1); }
#undef ML_STEP2
}

__device__ __forceinline__ void mixer_gmlp_item(const Params& p, int l, LAS unsigned char* lds, int item, int tid, int wave, int lane) {
    const int chunk = item >> 2, g = item & 3; const size_t tok0 = (size_t)chunk * 128;
    const bf16* Z = (const bf16*)(p.ws + WS_Z); bf16* BR1 = (bf16*)(p.ws + WS_BR) + 1 * BW;
    const float* ng = p.in[I_GMNG] + l * BW; const float* nb = p.in[I_GMNB] + l * BW;
    const float* wsp = p.in[I_GMWS] + ((size_t)(l * 4 + g) * 128) * 128; const float* bsp = p.in[I_GMBS] + (l * 4 + g) * 128;
    LAS float* vn = (LAS float*)lds;
    for (int r = 0; r < 16; ++r) { const int tk = wave * 16 + r;
        const v4u raw = *(const v4u*)(Z + (tok0 + tk) * ZC + ZC_GMV + 8 * lane); float x[8]; unpack8(raw, x); float s = 0.f;
#pragma unroll
        for (int i = 0; i < 8; ++i) { x[i] = gelu_tanh(x[i]); s += x[i]; }
        const float mean = wave_sum(s) * (1.f / 512.f); float ss = 0.f;
#pragma unroll
        for (int i = 0; i < 8; ++i) { x[i] -= mean; ss += x[i] * x[i]; }
        const float rstd = rsqrtf(wave_sum(ss) * (1.f / 512.f) + LN_EPS);
        if ((lane >> 4) == g) { const int cl = 8 * (lane & 15);
#pragma unroll
            for (int i = 0; i < 8; ++i) vn[tk * 128 + cl + i] = x[i] * rstd * ng[8 * lane + i] + nb[8 * lane + i]; }
    }
    __syncthreads();
    const int t = tid >> 2, cq = tid & 3; float acc[32];
#pragma unroll
    for (int i = 0; i < 32; ++i) acc[i] = 0.f;
    const float* wrow = wsp + (size_t)t * 128;
    for (int s = 0; s <= t; ++s) { const float w = wrow[s]; const LAS float* row = vn + s * 128 + cq * 32;
#pragma unroll
        for (int i4 = 0; i4 < 8; ++i4) { const v4f a = *(const LAS v4f*)(row + 4 * i4); acc[4 * i4] += w * a.x; acc[4 * i4 + 1] += w * a.y; acc[4 * i4 + 2] += w * a.z; acc[4 * i4 + 3] += w * a.w; } }
    const float bias = bsp[t];
#pragma unroll
    for (int i8 = 0; i8 < 4; ++i8) { const v4u raw = *(const v4u*)(Z + (tok0 + t) * ZC + ZC_GMU + g * 128 + cq * 32 + 8 * i8); float u[8]; unpack8(raw, u); float o[8];
#pragma unroll
        for (int i = 0; i < 8; ++i) o[i] = gelu_tanh(u[i]) * (acc[8 * i8 + i] + bias);
#if MERGE_FP8
        *(v2u*)((unsigned char*)(p.ws + WS_BR) + (tok0 + t) * BRW + 1 * BW + g * 128 + cq * 32 + 8 * i8) = (v2u){pk4_f8(o[0], o[1], o[2], o[3], BRSC), pk4_f8(o[4], o[5], o[6], o[7], BRSC)}; }
#else
        v4u w; w.x = pk2(o[0], o[1]); w.y = pk2(o[2], o[3]); w.z = pk2(o[4], o[5]); w.w = pk2(o[6], o[7]);
        *(v4u*)(BR1 + (tok0 + t) * BRW + g * 128 + cq * 32 + 8 * i8) = w; }
#endif
    __syncthreads();
}

__device__ __forceinline__ void vt_item(const Params& p, LAS unsigned char* lds, int item, int tid) {
    const int h = item & 3, n = item >> 2; const size_t t0 = (size_t)n * 64;
    const bf16* Z = (const bf16*)(p.ws + WS_Z); bf16* VT = (bf16*)(p.ws + WS_VT);
    LAS unsigned short* vs = (LAS unsigned short*)lds;
#pragma unroll
    for (int r = 0; r < 2; ++r) { const int idx = tid + 512 * r, tk = idx >> 4, c8 = idx & 15;
        *(LAS v4u*)(vs + tk * 136 + 8 * c8) = *(const v4u*)(Z + (t0 + tk) * ZC + ZC_SBV + h * 128 + 8 * c8); }
    __syncthreads();
    { const int d = tid >> 2, jq = tid & 3; unsigned w[8];
#pragma unroll
      for (int x = 0; x < 8; ++x) w[x] = (unsigned)vs[(16 * jq + 2 * x) * 136 + d] | ((unsigned)vs[(16 * jq + 2 * x + 1) * 136 + d] << 16);
      bf16* dst = VT + ((size_t)h * 128 + d) * T + t0 + 16 * jq;
      *(v4u*)dst = (v4u){w[0], w[1], w[2], w[3]}; *(v4u*)(dst + 8) = (v4u){w[4], w[5], w[6], w[7]}; }
    __syncthreads();
}
constexpr int KTP = 136, VTP = 72;
__device__ __forceinline__ void sb_unit(const Params& p, LAS unsigned char* lds, int unit, int tid, int wave, int lane) {
    const int h = unit >> 6, q0 = (unit & 63) * 128, g = lane >> 4, c = lane & 15; const int qrow = q0 + 16 * wave + c;
    const bf16* Z = (const bf16*)(p.ws + WS_Z); const bf16* VT = (const bf16*)(p.ws + WS_VT) + (size_t)h * 128 * T; bf16* BR0 = (bf16*)(p.ws + WS_BR);
    LAS unsigned short* Kt = (LAS unsigned short*)lds;
    LAS unsigned short* Vt = Kt + 2 * 64 * KTP;
    LAS int* flags = (LAS int*)(Vt + 2 * 128 * VTP);
    bf16x8_t qf[4];
#pragma unroll
    for (int ks = 0; ks < 4; ++ks) qf[ks] = *(const bf16x8_t*)(Z + (size_t)qrow * ZC + ZC_SBQ + h * 128 + 32 * ks + 8 * g);
    pg8::f32x4 acc[8];
#pragma unroll
    for (int dt = 0; dt < 8; ++dt) acc[dt] = (pg8::f32x4){0.f, 0.f, 0.f, 0.f};
    float racc = 0.f;
    v4u kr[2], vr[2];
    const int jt = (q0 >> 6) + 1;
#define SB_GLOAD(j_) do { _Pragma("unroll") for (int r = 0; r < 2; ++r) { const int idx = tid + 512 * r; \
        kr[r] = *(const v4u*)(Z + (size_t)(64 * (j_) + (idx >> 4)) * ZC + ZC_SBK + h * 128 + 8 * (idx & 15)); \
        vr[r] = *(const v4u*)(VT + (size_t)(idx >> 3) * T + 64 * (j_) + 8 * (idx & 7)); } } while (0)
#define SB_LWRITE(b_) do { _Pragma("unroll") for (int r = 0; r < 2; ++r) { const int idx = tid + 512 * r; \
        *(LAS v4u*)(Kt + (b_) * 64 * KTP + (idx >> 4) * KTP + 8 * (idx & 15)) = kr[r]; *(LAS v4u*)(Vt + (b_) * 128 * VTP + (idx >> 3) * VTP + 8 * (idx & 7)) = vr[r]; } } while (0)
    LDS_BAR();
    SB_GLOAD(jt); SB_LWRITE(0);
    LDS_BAR();
    for (int j = jt, it = 0; j >= 0; --j, ++it) {
        const int cur = it & 1;
        SB_GLOAD(j > 0 ? j - 1 : 0);
        const bool wdone = __all(racc > 104.f);
        if (64 * j < q0 + 16 * wave + 15 && !wdone) {
            const LAS unsigned short* Kc = Kt + cur * 64 * KTP; const LAS unsigned short* Vc = Vt + cur * 128 * VTP;
            pg8::f32x4 z[4];
#pragma unroll
            for (int s = 0; s < 4; ++s) { z[s] = (pg8::f32x4){0.f, 0.f, 0.f, 0.f};
#pragma unroll
                for (int ks = 0; ks < 4; ++ks) z[s] = __builtin_amdgcn_mfma_f32_16x16x32_bf16(*(const LAS bf16x8_t*)(Kc + (16 * s + c) * KTP + 32 * ks + 8 * g), qf[ks], z[s], 0, 0, 0); }
            float sp[4][4], t[4], xs[4]; bool mk[4][4];
#pragma unroll
            for (int s = 0; s < 4; ++s) { t[s] = 0.f;
#pragma unroll
                for (int r = 0; r < 4; ++r) { const int key = 64 * j + 16 * s + 4 * g + r; mk[s][r] = key < qrow; const float zz = z[s][r] * 0.08838834764831845f; z[s][r] = zz;
                    sp[s][r] = mk[s][r] ? softplusf_(zz) : 0.f; t[s] += sp[s][r]; } }
            float grand = 0.f, higher[4];
#pragma unroll
            for (int s = 3; s >= 0; --s) { float x = t[s]; float y = __shfl(x, lane + 16); x += (g < 3) ? y : 0.f; y = __shfl(x, lane + 32); x += (g < 2) ? y : 0.f;
                xs[s] = x - t[s];
                const float tot = __shfl(x, c); higher[s] = grand; grand += tot; }
            bf16x8_t pf[2];
#pragma unroll
            for (int s = 0; s < 4; ++s) { float a[4]; float e = 0.f;
#pragma unroll
                for (int r = 3; r >= 0; --r) { const float la = z[s][r] - sp[s][r] - (racc + higher[s] + xs[s] + e); a[r] = mk[s][r] ? __expf(la) : 0.f; e += sp[s][r]; }
                const unsigned w0 = pk2(a[0], a[1]), w1 = pk2(a[2], a[3]);
                if ((s & 1) == 0) { pf[s >> 1][0] = (short)(w0 & 0xffff); pf[s >> 1][1] = (short)(w0 >> 16); pf[s >> 1][2] = (short)(w1 & 0xffff); pf[s >> 1][3] = (short)(w1 >> 16); }
                else              { pf[s >> 1][4] = (short)(w0 & 0xffff); pf[s >> 1][5] = (short)(w0 >> 16); pf[s >> 1][6] = (short)(w1 & 0xffff); pf[s >> 1][7] = (short)(w1 >> 16); } }
            racc += grand;
#pragma unroll
            for (int dt = 0; dt < 8; ++dt)
#pragma unroll
                for (int k2 = 0; k2 < 2; ++k2) { const v2u lo = *(const LAS v2u*)(Vc + (16 * dt + c) * VTP + 32 * k2 + 4 * g), hi = *(const LAS v2u*)(Vc + (16 * dt + c) * VTP + 32 * k2 + 16 + 4 * g);
                    const v4u vv = (v4u){lo.x, lo.y, hi.x, hi.y};
                    acc[dt] = __builtin_amdgcn_mfma_f32_16x16x32_bf16(__builtin_bit_cast(bf16x8_t, vv), pf[k2], acc[dt], 0, 0, 0); }
        }
        const bool wd2 = __all(racc > 104.f);
        if (lane == 0) flags[cur * 8 + wave] = wd2 ? 1 : 0;
        SB_LWRITE(cur ^ 1);
        LDS_BAR();
        int alld = 1;
#pragma unroll
        for (int w = 0; w < 8; ++w) alld &= flags[cur * 8 + w];
        if (alld) break;
    }
#undef SB_GLOAD
#undef SB_LWRITE
#pragma unroll
#if MERGE_FP8
    for (int dt = 0; dt < 8; ++dt) *(unsigned*)((unsigned char*)BR0 + (size_t)qrow * BRW + h * 128 + 16 * dt + 4 * g) = pk4_f8(acc[dt][0], acc[dt][1], acc[dt][2], acc[dt][3], BRSC);
#else
    for (int dt = 0; dt < 8; ++dt) { v2u w; w.x = pk2(acc[dt][0], acc[dt][1]); w.y = pk2(acc[dt][2], acc[dt][3]); *(v2u*)(BR0 + (size_t)qrow * BRW + h * 128 + 16 * dt + 4 * g) = w; }
#endif
}

__device__ __forceinline__ void phase_mixers(const Params& p, int l, LAS unsigned char* lds, int wg, int G, int tid, int wave, int lane, const XcdBarrier& bar) {
#if defined(PROBE_SPLIT)
    if (wg < 16) gdn_seq2(p, lds, wg, tid, wave, lane); else if (wg < 36) ml_seq2(p, lds, wg - 16, tid, wave, lane);
    xcd_barrier(bar);
    const int w2 = wg, G2 = G;
#else
    if (wg < 16) { gdn_seq2(p, lds, wg, tid, wave, lane); return; }
    if (wg < 36) { ml_seq2(p, lds, wg - 16, tid, wave, lane); return; }
    const int w2 = wg - 36, G2 = G - 36;
#endif
    for (int it = w2; it < 256; it += G2) mixer_gmlp_item(p, l, lds, it, tid, wave, lane);
    for (int it = w2; it < 256; it += G2) sb_unit(p, lds, it, tid, wave, lane);
#if !defined(PROBE_CONV0)
    __syncthreads();
#if defined(PROBE_CONVDUP)
#pragma nounroll
    for (int rep = 0; rep < 2; ++rep)
#endif
    phase_convert<1>(p, l, lds, w2 * 8 + wave, G2 * 8, wave, lane
#if defined(PROBE_CONVDUP)
        , (PROBE_CONVDUP == 2) && rep == 1
#endif
        );
#endif
}

__device__ __forceinline__ void phase_post(const Params& p, int l, int gw, int NGW, int lane) {
    const bf16* Z = (const bf16*)(p.ws + WS_Z); const float* GO = (const float*)(p.ws + WS_GO); const float* HO = (const float*)(p.ws + WS_HO); const float* HDEN = (const float*)(p.ws + WS_HDEN);
    bf16* BR2 = (bf16*)(p.ws + WS_BR) + 2 * BW; bf16* BR3 = (bf16*)(p.ws + WS_BR) + 3 * BW;
    const float* gng = p.in[I_GDNNG] + l * 128; const float* mng = p.in[I_MLNG] + l * BW;
    for (int t = gw; t < T; t += NGW) {
        {   const v4f a0 = *(const v4f*)(GO + (size_t)t * BW + 8 * lane), a1 = *(const v4f*)(GO + (size_t)t * BW + 8 * lane + 4); float o[8] = {a0.x, a0.y, a0.z, a0.w, a1.x, a1.y, a1.z, a1.w}; float ss = 0.f;
#pragma unroll
            for (int i = 0; i < 8; ++i) ss += o[i] * o[i];
            const float r = rsqrtf(sum16(ss) * (1.f / 128.f) + LN_EPS);
            const v4u graw = *(const v4u*)(Z + (size_t)t * ZC + ZC_GDNG + 8 * lane); float gt[8]; unpack8(graw, gt);
#pragma unroll
            for (int i = 0; i < 8; ++i) o[i] = o[i] * r * gng[(8 * lane + i) & 127] * siluf_(gt[i]);
#if MERGE_FP8
            *(v2u*)((unsigned char*)(p.ws + WS_BR) + (size_t)t * BRW + 2 * BW + 8 * lane) = (v2u){pk4_f8(o[0], o[1], o[2], o[3], BRSC), pk4_f8(o[4], o[5], o[6], o[7], BRSC)}; }
#else
            v4u w; w.x = pk2(o[0], o[1]); w.y = pk2(o[2], o[3]); w.z = pk2(o[4], o[5]); w.w = pk2(o[6], o[7]); *(v4u*)(BR2 + (size_t)t * BRW + 8 * lane) = w; }
#endif
        {   const v4f a0 = *(const v4f*)(HO + (size_t)t * BW + 8 * lane), a1 = *(const v4f*)(HO + (size_t)t * BW + 8 * lane + 4); float o[8] = {a0.x, a0.y, a0.z, a0.w, a1.x, a1.y, a1.z, a1.w}; float ss = 0.f;
            const float dn = 1.f / fmaxf(fabsf(HDEN[(size_t)t * 4 + (lane >> 4)]), 1.f);
#pragma unroll
            for (int i = 0; i < 8; ++i) { o[i] *= dn; ss += o[i] * o[i]; }
            const float r = rsqrtf(sum16(ss) * (1.f / 128.f) + LN_EPS);
            const v4u graw = *(const v4u*)(Z + (size_t)t * ZC + ZC_MLO + 8 * lane); float gt[8]; unpack8(graw, gt);
#pragma unroll
            for (int i = 0; i < 8; ++i) o[i] = o[i] * r * mng[8 * lane + i] * sigmoidf_(gt[i]);
#if MERGE_FP8
            *(v2u*)((unsigned char*)(p.ws + WS_BR) + (size_t)t * BRW + 3 * BW + 8 * lane) = (v2u){pk4_f8(o[0], o[1], o[2], o[3], BRSC), pk4_f8(o[4], o[5], o[6], o[7], BRSC)}; }
#else
            v4u w; w.x = pk2(o[0], o[1]); w.y = pk2(o[2], o[3]); w.z = pk2(o[4], o[5]); w.w = pk2(o[6], o[7]); *(v4u*)(BR3 + (size_t)t * BRW + 8 * lane) = w; }
#endif
    }
}

__device__ __forceinline__ void ln_row(const float* yrow, const float* g, const float* b, int lane, v4f (&v)[8]) {
    const v4f* yr = (const v4f*)yrow + lane; float s = 0.f;
#pragma unroll
    for (int j = 0; j < 8; ++j) { v[j] = yr[64 * j]; s += (v[j].x + v[j].y) + (v[j].z + v[j].w); }
    const float mean = wave_sum(s) * (1.f / D); float s2 = 0.f;
#pragma unroll
    for (int j = 0; j < 8; ++j) { v[j] = v[j] - mean; s2 += (v[j].x * v[j].x + v[j].y * v[j].y) + (v[j].z * v[j].z + v[j].w * v[j].w); }
    const float rstd = rsqrtf(wave_sum(s2) * (1.f / D) + LN_EPS);
#pragma unroll
    for (int j = 0; j < 8; ++j) { const v4f gg = ((const v4f*)g)[lane + 64 * j], bb = ((const v4f*)b)[lane + 64 * j]; v[j] = v[j] * rstd * gg + bb; }
}
constexpr int RT_XP = 2052;
constexpr int RT_TAB = 131072 + 1024;
__device__ __forceinline__ void phase_ln1_router(const Params& p, int l, LAS unsigned char* lds, int wg, int G, int wave, int lane, int cnt_shift = 0) {
    const float* Y = (const float*)(p.ws + WS_Y); float* X1 = (float*)(p.ws + WS_X1); bf16* X1B = (bf16*)(p.ws + WS_X1B); int* LIST = (int*)(p.ws + WS_LIST); float* WL = (float*)(p.ws + WS_WL); unsigned* SLOT = (unsigned*)(p.ws + WS_SLOT);
    unsigned* cnt = (unsigned*)(p.ws + WS_CTL) + CW_CNT + l * 4096 + cnt_shift;
    const float* g1 = p.in[I_LN1G] + (size_t)l * D; const float* b1 = p.in[I_LN1B] + (size_t)l * D;
    const float* wr = p.in[I_WR] + (size_t)l * D * NE; const float rbias = p.in[I_RB][l * NE + lane];
    LAS float* xt = (LAS float*)lds;
    LAS float* part = (LAS float*)lds;
    LAS unsigned char* selm = lds + RT_TAB; LAS unsigned char* rkm = selm + 4096; LAS float* wtm = (LAS float*)(rkm + 4096); LAS unsigned* basem = (LAS unsigned*)(wtm + 4096);
    const int n_l = lane & 15, kq = lane >> 4;
    int gi = 0;
    for (int tg = wg; tg < T / 16; tg += G, ++gi) {
        {   v4f va[8], vb[8]; const size_t m0 = (size_t)tg * 16 + 2 * wave;
            const v4f* ya = (const v4f*)(Y + m0 * D) + lane; const v4f* yb = (const v4f*)(Y + (m0 + 1) * D) + lane;
#pragma unroll
            for (int j = 0; j < 8; ++j) { va[j] = ya[64 * j]; vb[j] = yb[64 * j]; }
            float sa = 0.f, sb = 0.f;
#pragma unroll
            for (int j = 0; j < 8; ++j) { sa += (va[j].x + va[j].y) + (va[j].z + va[j].w); sb += (vb[j].x + vb[j].y) + (vb[j].z + vb[j].w); }
            const float ma = wave_sum(sa) * (1.f / D), mb = wave_sum(sb) * (1.f / D); float qa = 0.f, qb = 0.f;
#pragma unroll
            for (int j = 0; j < 8; ++j) { va[j] = va[j] - ma; vb[j] = vb[j] - mb; qa += (va[j].x * va[j].x + va[j].y * va[j].y) + (va[j].z * va[j].z + va[j].w * va[j].w); qb += (vb[j].x * vb[j].x + vb[j].y * vb[j].y) + (vb[j].z * vb[j].z + vb[j].w * vb[j].w); }
            const float ra = rsqrtf(wave_sum(qa) * (1.f / D) + LN_EPS), rb = rsqrtf(wave_sum(qb) * (1.f / D) + LN_EPS);
#pragma unroll
            for (int j = 0; j < 8; ++j) { const v4f gg = ((const v4f*)g1)[lane + 64 * j], bb = ((const v4f*)b1)[lane + 64 * j]; va[j] = va[j] * ra * gg + bb; vb[j] = vb[j] * rb * gg + bb; }
#pragma unroll
            for (int rr = 0; rr < 2; ++rr) { const size_t m = m0 + rr; v4f* xo = (v4f*)(X1 + m * D) + lane;
#pragma unroll
                for (int j = 0; j < 8; ++j) { const v4f v = rr ? vb[j] : va[j]; xo[64 * j] = v;
#if MOE_UP_FP8
                    { unsigned w = 0; w = __builtin_amdgcn_cvt_pk_fp8_f32(v.x, v.y, w, false); w = __builtin_amdgcn_cvt_pk_fp8_f32(v.z, v.w, w, true); ((unsigned*)((unsigned char*)X1B + m * D))[lane + 64 * j] = w; }
#else
                    { v2u o; o.x = pk2(v.x, v.y); o.y = pk2(v.z, v.w); ((v2u*)(X1B + m * D))[lane + 64 * j] = o; }
#endif
                    *(LAS v4f*)(xt + (2 * wave + rr) * RT_XP + 4 * lane + 256 * j) = v; } } }
        __syncthreads();
        {   pg8::f32x4 acc[4];
#pragma unroll
            for (int i = 0; i < 4; ++i) acc[i] = (pg8::f32x4){0.f, 0.f, 0.f, 0.f};
            const float* wb = wr + (size_t)(256 * wave + 4 * kq) * NE + 4 * n_l;
            const LAS float* xa = xt + n_l * RT_XP + 256 * wave + 4 * kq;
            v4f bwa[16], bwb[16];
#define RT_LOADW(dst, sb_) do { _Pragma("unroll") for (int q = 0; q < 16; ++q) dst[q] = *(const v4f*)(wb + (size_t)(16 * (4 * (sb_) + (q >> 2)) + (q & 3)) * NE); } while (0)
#define RT_MMA(src, sb_) do { _Pragma("unroll") for (int sg = 0; sg < 4; ++sg) { const v4f a4 = *(const LAS v4f*)(xa + 16 * (4 * (sb_) + sg)); \
                _Pragma("unroll") for (int c = 0; c < 4; ++c) { const v4f b4 = src[sg * 4 + c]; const float a = c == 0 ? a4.x : c == 1 ? a4.y : c == 2 ? a4.z : a4.w; \
                    acc[0] = __builtin_amdgcn_mfma_f32_16x16x4f32(a, b4.x, acc[0], 0, 0, 0); acc[1] = __builtin_amdgcn_mfma_f32_16x16x4f32(a, b4.y, acc[1], 0, 0, 0); \
                    acc[2] = __builtin_amdgcn_mfma_f32_16x16x4f32(a, b4.z, acc[2], 0, 0, 0); acc[3] = __builtin_amdgcn_mfma_f32_16x16x4f32(a, b4.w, acc[3], 0, 0, 0); } } } while (0)
            RT_LOADW(bwa, 0);
#pragma unroll 1
            for (int h = 0; h < 2; ++h) {
                RT_LOADW(bwb, 1); RT_MMA(bwa, 0);
                if (h == 0) RT_LOADW(bwa, 2);
                RT_MMA(bwb, 1);
                wb += (size_t)128 * NE; xa += 128; asm volatile("" : "+v"(wb));
            }
#undef RT_LOADW
#undef RT_MMA
            __syncthreads();
#pragma unroll
            for (int j = 0; j < 4; ++j) *(LAS v4f*)(part + (wave * 16 + 4 * kq + j) * 64 + 4 * n_l) = (v4f){acc[0][j], acc[1][j], acc[2][j], acc[3][j]}; }
        __syncthreads();
#pragma unroll 1
        for (int rr = 0; rr < 2; ++rr) { const int lr = wave + 8 * rr; float logit = 0.f;
#pragma unroll
            for (int w = 0; w < 8; ++w) logit += part[(w * 16 + lr) * 64 + lane];
            const float s = sigmoidf_(logit), biased = s + rbias;
            const float m1 = max8(biased); const float li = (float)(lane & 7);
            const float first = min8(biased == m1 ? li : 8.f);
            const float m2 = max8(li == first ? -INFINITY : biased);
            const float gs = m1 + m2; const int myg = lane >> 3; int grank = 0;
#pragma unroll
            for (int g2 = 0; g2 < 8; ++g2) { const float o = __builtin_bit_cast(float, __builtin_amdgcn_readlane(__builtin_bit_cast(int, gs), g2 * 8)); grank += (o > gs || (o == gs && g2 < myg)) ? 1 : 0; }
            const float masked = grank < 4 ? biased : -INFINITY; int rank = 0;
#pragma unroll
            for (int e2 = 0; e2 < 64; ++e2) { const float o = __builtin_bit_cast(float, __builtin_amdgcn_readlane(__builtin_bit_cast(int, masked), e2)); rank += (o > masked || (o == masked && e2 < lane)) ? 1 : 0; }
            const float wsel = rank < 6 ? s : 0.f; const float tot = wave_sum(wsel);
            const int ri = gi * 16 + lr;
            selm[ri * 64 + lane] = (rank < 6) ? 1 : 0; rkm[ri * 64 + lane] = (unsigned char)rank; wtm[ri * 64 + lane] = wsel / tot * 2.5f; }
        __syncthreads();
    }
    const int nrows = gi * 16;
    if (wave == 0) { unsigned n = 0;
        for (int r = 0; r < nrows; ++r) n += selm[r * 64 + lane];
        unsigned base = 0; if (n && !(PROBE_NOATOM && cnt_shift)) base = __hip_atomic_fetch_add(cnt + 64 * lane, n, __ATOMIC_RELAXED, __HIP_MEMORY_SCOPE_AGENT);
        basem[lane] = base; }
    __syncthreads();
    for (int ri = wave; ri < nrows; ri += 8) { unsigned pos = basem[lane];
        for (int r = 0; r < ri; ++r) pos += selm[r * 64 + lane];
        if (selm[ri * 64 + lane]) { const size_t m = (size_t)(wg + (ri >> 4) * G) * 16 + (ri & 15); const int rk = rkm[ri * 64 + lane];
            LIST[lane * T + pos] = (int)m; WL[lane * T + pos] = wtm[ri * 64 + lane]; SLOT[m * 8 + rk] = ((unsigned)lane << 16) | pos; } }
    __syncthreads();
}
__device__ __forceinline__ void phase_combine_ln2(const Params& p, int l, float* dst, int gw, int NGW, int lane) {
    const float* X1 = (const float*)(p.ws + WS_X1); const bf16* YE = (const bf16*)(p.ws + WS_YEXP); const unsigned* SLOT = (const unsigned*)(p.ws + WS_SLOT);
    const unsigned* cnt = (const unsigned*)(p.ws + WS_CTL) + CW_CNT + l * 4096;
    const float* g2 = p.in[I_LN2G] + (size_t)l * D; const float* b2 = p.in[I_LN2B] + (size_t)l * D;
    const int tiles = ((int)cnt[64 * lane] + 255) >> 8; const float incl = wave_scan_incl((float)tiles);
    const int toff = (int)incl - tiles;
    const int tsh = __builtin_amdgcn_readlane((int)incl, 63);
    for (int m = gw; m < T; m += NGW) {
        v4f v[8]; const v4f* xr = (const v4f*)(X1 + (size_t)m * D) + lane;
#pragma unroll
        for (int j = 0; j < 8; ++j) v[j] = xr[64 * j] * ALPHA;
#pragma unroll
        for (int k = 0; k < 7; ++k) { size_t row;
            if (k == 0) row = (size_t)tsh * 256 + m;
            else { const unsigned s = __builtin_amdgcn_readfirstlane(SLOT[(size_t)m * 8 + (k - 1)]); const int e = (int)(s >> 16); row = (size_t)__builtin_amdgcn_readlane(toff, e) * 256 + (s & 0xffffu); }
            const v2u* yr = (const v2u*)(YE + row * D) + lane;
#pragma unroll
            for (int j = 0; j < 8; ++j) { const v2u y = yr[64 * j]; v[j].x += bflo(y.x); v[j].y += bfhi(y.x); v[j].z += bflo(y.y); v[j].w += bfhi(y.y); } }
        float s = 0.f;
#pragma unroll
        for (int j = 0; j < 8; ++j) s += (v[j].x + v[j].y) + (v[j].z + v[j].w);
        const float mean = wave_sum(s) * (1.f / D); float s2 = 0.f;
#pragma unroll
        for (int j = 0; j < 8; ++j) { v[j] = v[j] - mean; s2 += (v[j].x * v[j].x + v[j].y * v[j].y) + (v[j].z * v[j].z + v[j].w * v[j].w); }
        const float rstd = rsqrtf(wave_sum(s2) * (1.f / D) + LN_EPS);
        v4f* xo = (v4f*)(dst + (size_t)m * D) + lane;
#pragma unroll
        for (int j = 0; j < 8; ++j) { const v4f gg = ((const v4f*)g2)[lane + 64 * j], bb = ((const v4f*)b2)[lane + 64 * j]; xo[64 * j] = v[j] * rstd * gg + bb; }
    }
}

constexpr int NPH = 11;
template <class S> struct DupOrder {
    S s; int n;
    __device__ __forceinline__ bool next(int i, Unit& u) const { return s.next(i >= n ? i - n : i, u); }
    __device__ __forceinline__ int row_token(int i, int r) const { return s.row_token(i >= n ? i - n : i, r); }
    __device__ __forceinline__ void a_ready(const Unit& u) const { s.a_ready(u); }
    __device__ __forceinline__ void done(const Unit& u) const { s.done(u); }
};
template <class S> __device__ __forceinline__ int count_units(const S& s) { Unit u; int n = 0; while (n < 64 && s.next(n, u)) ++n; return n; }
#define ORDER_T(k, T) typename std::conditional<PROBE_DUP == (k), DupOrder<T>, T>::type
template <class S> __device__ __forceinline__ DupOrder<S> make_order(const S& s, std::true_type) { DupOrder<S> d{s, count_units(s)}; d.n = count_units(s); return d; }
template <class S> __device__ __forceinline__ S make_order(const S& s, std::false_type) { return s; }
#define MAKE_ORDER(k, s) make_order(s, std::integral_constant<bool, PROBE_DUP == (k)>())
template <int l>
__device__ __forceinline__ void run_layer(const Params& p, LAS unsigned char* lds, const XcdBarrier& bar, int tid, int lane, int wave, int G, int wg, int gw, int NGW) {
    unsigned char* ws = p.ws;
    {
        const float* xin = (l == 0) ? p.in[I_X] : (const float*)(ws + WS_XCUR);
        float* xout = (l == NL - 1) ? p.out : (float*)(ws + WS_XCUR);
#ifndef PROBE_DUP
#define PROBE_DUP (-1)
#endif
#define IS_GEMM_PH(k) ((k) == 1 || (k) == 5 || (k) == 6 || (k) == 8 || (k) == 9)
#define REP(k) _Pragma("nounroll") for (int _r = 0; _r < ((PROBE_DUP == (k) && !IS_GEMM_PH(k)) ? 2 + (p.ph_lo >> 20) : 1); ++_r)
#ifndef PH_MASK
#define PH_MASK 0x7ff
#endif
#define RUN(k) (((PH_MASK >> (k)) & 1) && p.ph_lo <= l * NPH + (k) && l * NPH + (k) < p.ph_hi)
#define SEAM(k) do { if (l * NPH + (k) + 1 < p.ph_hi) xcd_barrier(bar); } while (0)
        if (RUN(0)) { REP(0) { phase_convert<0>(p, l, lds, gw, NGW, wave, lane);
#if defined(PROBE_CONV0)
            phase_convert<1>(p, l, lds, gw, NGW, wave, lane);
#endif
 phase_xprep(p, l, xin, lds, gw, NGW, tid, lane); } SEAM(0); }
        if (RUN(1)) { REP(1) { pg8::Gemm g{(const bf16*)(ws + WS_XB), (const bf16*)(ws + WS_WIN), T, ZC, D / 2, D / 2, D / 2}; pg8::StaticOrder S; S.init(T, ZC, G, wg);
            pg8::EpiBf16<0> E{(bf16*)(ws + WS_Z), ZC, nullptr, 0, 0, 1.f / 64.f};
            auto S2 = MAKE_ORDER(1, S); pg8::gemm_phase<pg8::EpiBf16<0>, ORDER_T(1, pg8::StaticOrder), true, true, true>(lds, g, S2, E); } SEAM(1); }
        if (RUN(2)) { REP(2) { for (int it = wg; it < 1536; it += G) { if (it < 512) gdn_pre_item(p, l, lds, it, tid, wave, lane); else if (it < 1024) ml_pre_item(p, l, lds, it - 512, tid, wave, lane); else vt_item(p, lds, it - 1024, tid); } } SEAM(2); }
        if (RUN(3)) { REP(3) { phase_mixers(p, l, lds, wg, G, tid, wave, lane, bar); } SEAM(3); }
        if (RUN(4)) { REP(4) { phase_post(p, l, gw, NGW, lane); } SEAM(4); }
        if (RUN(5)) { REP(5) { constexpr int KM = MERGE_FP8 ? BRW / 2 : BRW; pg8::Gemm g{(const bf16*)(ws + WS_BR), (const bf16*)(ws + WS_WBR), T, D, KM, KM, KM}; pg8::StaticOrder S; S.init(T, D, G, wg);
            EpiMergeH E{(const bf16*)(ws + WS_Z), (bf16*)(ws + WS_MSUM)};
            auto S2 = MAKE_ORDER(5, S); pg8::gemm_phase<EpiMergeH, ORDER_T(5, pg8::StaticOrder), true, true, MERGE_FP8 != 0>(lds, g, S2, E); } SEAM(5); }
        if (RUN(6)) { REP(6) { pg8::Gemm g{(const bf16*)(ws + WS_MSUM), (const bf16*)(ws + WS_WOUT), T, D, D / 2, D / 2, D / 2}; pg8::StaticOrder S; S.init(T, D, G, wg);
            EpiResid E{xin, (float*)(ws + WS_Y), 1.f / 64.f};
            auto S2 = MAKE_ORDER(6, S); pg8::gemm_phase<EpiResid, ORDER_T(6, pg8::StaticOrder), true, true, true>(lds, g, S2, E); } SEAM(6); }
        if (RUN(7)) { REP(7) { phase_ln1_router(p, l, lds, wg, G, wave, lane, (PROBE_DUP == 7 && _r == 0) ? 16384 : 0); } SEAM(7); }
        if (RUN(8)) { REP(8) { const unsigned* cnt = (const unsigned*)(ws + WS_CTL) + CW_CNT + l * 4096; MoeTab M(lds); moe_tables(M, cnt, tid, lane, wave);
            UpOrder S{M, 0}; S.n = up_order_build(M, (const int*)(ws + WS_LIST), (const float*)(ws + WS_WL), wg, G, tid);
            constexpr int KU = MOE_UP_FP8 ? D / 2 : D;
            pg8::Gemm g{(const bf16*)(ws + WS_X1B), (const bf16*)(ws + WS_WUP), T, NEX * 1024, KU, KU, KU};
            EpiGluSparse E{(LAS const float*)M.wt, (bf16*)(ws + WS_HB)};
            auto S2 = MAKE_ORDER(8, S); pg8::gemm_phase_gather<EpiGluSparse, ORDER_T(8, UpOrder), MOE_UP_FP8 != 0>(lds, g, S2, E); } SEAM(8); }
        if (RUN(9)) { REP(9) { const unsigned* cnt = (const unsigned*)(ws + WS_CTL) + CW_CNT + l * 4096; MoeTab M(lds); moe_tables(M, cnt, tid, lane, wave);
            DownOrder S{M, G, wg, 8 * M.t[65]};
            constexpr int KD = MOE_DN_FP8 ? ED / 2 : ED;
            pg8::Gemm g{(const bf16*)(ws + WS_HB), (const bf16*)(ws + WS_WDN), HROWS, NEX * D, KD, KD, KD};
            EpiYexp E{(bf16*)(ws + WS_YEXP)};
            auto S2 = MAKE_ORDER(9, S); pg8::gemm_phase<EpiYexp, ORDER_T(9, DownOrder), true, true, MOE_DN_FP8 != 0>(lds, g, S2, E); } SEAM(9); }
        if (RUN(10)) { REP(10) { phase_combine_ln2(p, l, xout, gw, NGW, lane); } SEAM(10); }
#undef RUN
#undef SEAM
    }
}
__global__ void __launch_bounds__(512, 2) fwd_kernel(Params p) {
    extern __shared__ __attribute__((aligned(16))) unsigned char lds_raw[];
    LAS unsigned char* lds = (LAS unsigned char*)lds_raw;
    const int tid = threadIdx.x, lane = tid & 63, wave = __builtin_amdgcn_readfirstlane(tid >> 6);
    const int G = gridDim.x, wg = blockIdx.x, gw = wg * 8 + wave, NGW = G * 8;
    volatile LAS unsigned* MISC = (volatile LAS unsigned*)(lds + MISC_OFF);
    if (tid < 32) MISC[tid] = 0u;
    __syncthreads();
    unsigned* ctl = (unsigned*)(p.ws + WS_CTL);
    const bool multi = (p.ph_hi - p.ph_lo) > 1;
    XcdBarrier bar; bar.bar = ctl + CW_BAR; bar.x = 0; bar.st = nullptr;
    if (multi) bar = xcd_barrier_post(ctl + CW_BAR, MISC + 8);
    run_layer<0>(p, lds, bar, tid, lane, wave, G, wg, gw, NGW);
    run_layer<1>(p, lds, bar, tid, lane, wave, G, wg, gw, NGW);
}

#ifndef MK_MULTI_LAUNCH
#define MK_MULTI_LAUNCH 0
#endif
extern "C" void kernel_launch(void* const* d_in, const int* in_sizes, int n_in, void* d_out, int out_size, void* d_ws, size_t ws_size, hipStream_t stream) {
    static int grid = 0;
    if (grid == 0) {
        if (n_in != 27 || out_size != T * D || ws_size < WS_END) { fprintf(stderr, "kernel_launch: unexpected shapes (n_in %d out %d ws %zu need %zu)\n", n_in, out_size, ws_size, (size_t)WS_END); grid = -1; return; }
        int dev = 0, cus = 0, per_cu = 0;
        if (hipGetDevice(&dev) != hipSuccess || hipDeviceGetAttribute(&cus, hipDeviceAttributeMultiprocessorCount, dev) != hipSuccess) { grid = -1; return; }
        if (hipFuncSetAttribute((const void*)fwd_kernel, hipFuncAttributeMaxDynamicSharedMemorySize, LDS_BYTES) != hipSuccess) { fprintf(stderr, "kernel_launch: hipFuncSetAttribute failed\n"); grid = -1; return; }
        if (hipOccupancyMaxActiveBlocksPerMultiprocessor(&per_cu, (const void*)fwd_kernel, 512, LDS_BYTES) != hipSuccess || per_cu < 1) { fprintf(stderr, "kernel_launch: occupancy query says %d\n", per_cu); }
        (void)hipGetLastError();
        grid = cus;
    }
    if (grid < 0) return;
    (void)hipMemsetAsync((char*)d_ws + WS_CTL, 0, CTL_ZERO_BYTES, stream);
    Params p{};
    for (int i = 0; i < 27; ++i) p.in[i] = (const float*)d_in[i];
    p.out = (float*)d_out; p.ws = (unsigned char*)d_ws;
#if MK_MULTI_LAUNCH
    for (int ph = 0; ph < NL * NPH; ++ph) { p.ph_lo = ph; p.ph_hi = ph + 1; hipLaunchKernelGGL(fwd_kernel, dim3(grid), dim3(512), LDS_BYTES, stream, p); }
#else
    p.ph_lo = 0; p.ph_hi = NL * NPH; hipLaunchKernelGGL(fwd_kernel, dim3(grid), dim3(512), LDS_BYTES, stream, p);
#endif
}
```

```cpp
#include <hip/hip_runtime.h>
#include <cstdio>
#include <cstdint>
#include <type_traits>
namespace pg8 {
#define PG8_LAS __attribute__((address_space(3)))
typedef unsigned short bf16_t;
typedef short bf16x8 __attribute__((ext_vector_type(8)));
typedef float f32x4 __attribute__((ext_vector_type(4)));
typedef unsigned u32x4 __attribute__((ext_vector_type(4)));
constexpr int BM = 256, BK = 64, HALF = 128, HTB = HALF * BK * 2  , STAGE_BYTES = 8 * HTB, NXCD = 8, WGM = 8;

__host__ __device__ __forceinline__ int lds_byte(int r, int c) { const int st = (r >> 4) * 2 + (c >> 5), rr = r & 15, cc = c & 31, ob = rr * 64 + cc * 2; return st * 1024 + (ob ^ (((ob >> 9) & 1) << 5)); }
__host__ __device__ __forceinline__ void stage_rc(int b, int& R, int& C) { const int st = b / 1024, sb = b % 1024, swz = sb ^ (((sb >> 9) & 1) << 5); R = (st >> 1) * 16 + swz / 64; C = (st & 1) * 32 + (swz % 64) / 2; }
__host__ __device__ __forceinline__ int perm32(int rho) { const int n = rho >> 4, i = rho & 15; return 8 * (i >> 2) + 4 * n + (i & 3); }

struct Unit { int pm, pn, aux; };
struct Gemm { const bf16_t* A; const bf16_t* Bt; int M, N, K, lda, ldb; };

struct StaticOrder {
    int nM, nN, nwg, G, c;
    __host__ __device__ void init(int M, int N, int G_, int c_) { nM = M / BM; nN = N / BM; nwg = nM * nN; G = G_; c = c_; }
    __host__ __device__ bool next(int i, Unit& u) const {
        const long L = (long)i * G + c; if (L >= nwg) return false;
        int wgid = (int)L; { const int q = nwg / NXCD, r = nwg % NXCD, xcd = wgid % NXCD, off = wgid / NXCD; wgid = (xcd < r ? xcd * (q + 1) : r * (q + 1) + (xcd - r) * q) + off; }
        const int nig = WGM * nN, gid = wgid / nig, fm = gid * WGM, gsz = (nM - fm) < WGM ? (nM - fm) : WGM;
        u.pm = fm + ((wgid % nig) % gsz); u.pn = (wgid % nig) / gsz; return true;
    }
    __device__ __forceinline__ void a_ready(const Unit&) const {}
    __device__ __forceinline__ void done(const Unit&) const {}
};

__device__ __forceinline__ unsigned cvt_pk_bf16(float lo, float hi) { unsigned r; asm volatile("v_cvt_pk_bf16_f32 %0, %1, %2" : "=v"(r) : "v"(lo), "v"(hi)); return r; }
typedef float f32x2 __attribute__((ext_vector_type(2)));
__device__ __forceinline__ f32x2 gelu_pk(f32x2 v) {
    const f32x2 av = __builtin_elementwise_abs(v), d = av * 0.2316418882f + 1.0f;
    f32x2 t; t.x = __builtin_amdgcn_rcpf(d.x); t.y = __builtin_amdgcn_rcpf(d.y);
    f32x2 q = t * 0.5307027145f + (-0.7265760135f); q = q * t + 0.7107068705f; q = q * t + (-0.142248368f); q = q * t + 0.127414796f; q = q * t;
    const f32x2 s = (v * v) * (-0.72134752044f);
    f32x2 e; e.x = __builtin_amdgcn_exp2f(s.x); e.y = __builtin_amdgcn_exp2f(s.y);
    const f32x2 m = v * (q * e), r = v - m;
    f32x2 o; o.x = v.x < 0.f ? m.x : r.x; o.y = v.y < 0.f ? m.y : r.y; return o;
}

template <int ACT  > struct EpiBf16 {
    static constexpr bool PERM = true, AFTER_DRAIN = false; static constexpr int MID = 0; static_assert(ACT == 0 || ACT == 1, "EpiBf16: ACT is 0 (none) or 1 (gelu_pk)");
    bf16_t* O; int ldc; const float* bias; int split_cols; size_t split_stride; float scale0;
    __device__ __forceinline__ void operator()(const f32x4 (&acc)[2][2][4][2], const Unit& u, int wr, int wc, int fr, int fq) const {
        const int row0 = u.pm * BM + wr * 64 + fr; int colt = u.pn * BM; bf16_t* base = O;
        float sc = scale0; if (split_cols) { const int t = colt / split_cols; base += (size_t)t * split_stride; colt -= t * split_cols; if (t != 0) sc = 1.f; }
        const int col0 = colt + wc * 32 + 8 * fq, bcol0 = u.pn * BM + wc * 32 + 8 * fq;
        f32x4 bv[2][2];
#pragma unroll
        for (int bj = 0; bj < 2; ++bj)
#pragma unroll
            for (int n = 0; n < 2; ++n) bv[bj][n] = bias ? *(const f32x4*)(bias + bcol0 + bj * HALF + 4 * n) : (f32x4){0.f, 0.f, 0.f, 0.f};
#pragma unroll
        for (int ai = 0; ai < 2; ++ai)
#pragma unroll
            for (int m = 0; m < 4; ++m) { bf16_t* rowp = base + (size_t)(row0 + ai * HALF + m * 16) * ldc + col0;
#pragma unroll
                for (int bj = 0; bj < 2; ++bj) { f32x4 v0 = acc[ai][bj][m][0] + bv[bj][0], v1 = acc[ai][bj][m][1] + bv[bj][1];
                    if (ACT == 1) { f32x2 a = gelu_pk((f32x2){v0[0], v0[1]}), b = gelu_pk((f32x2){v0[2], v0[3]}), c = gelu_pk((f32x2){v1[0], v1[1]}), d = gelu_pk((f32x2){v1[2], v1[3]});
                        v0 = (f32x4){a.x, a.y, b.x, b.y}; v1 = (f32x4){c.x, c.y, d.x, d.y}; }
                    v0 = v0 * sc; v1 = v1 * sc; u32x4 w; w.x = cvt_pk_bf16(v0[0], v0[1]); w.y = cvt_pk_bf16(v0[2], v0[3]); w.z = cvt_pk_bf16(v1[0], v1[1]); w.w = cvt_pk_bf16(v1[2], v1[3]);
                    *(u32x4*)(rowp + bj * HALF) = w; } }
    }
};

typedef int i32x8 __attribute__((ext_vector_type(8)));
__device__ __forceinline__ i32x8 cat8(const bf16x8 a, const bf16x8 b) { typedef int i32x4 __attribute__((ext_vector_type(4))); const i32x4 x = __builtin_bit_cast(i32x4, a), y = __builtin_bit_cast(i32x4, b); return (i32x8){x[0], x[1], x[2], x[3], y[0], y[1], y[2], y[3]}; }
__device__ __forceinline__ bf16x8 lo8(const i32x8 v) { typedef int i32x4 __attribute__((ext_vector_type(4))); return __builtin_bit_cast(bf16x8, __builtin_shufflevector(v, v, 0, 1, 2, 3)); }
__device__ __forceinline__ bf16x8 hi8(const i32x8 v) { typedef int i32x4 __attribute__((ext_vector_type(4))); return __builtin_bit_cast(bf16x8, __builtin_shufflevector(v, v, 4, 5, 6, 7)); }
template <class Epi, class Sched, bool ALIGN_EPI = false, bool SP2 = false, bool FP8 = false>
__device__ __forceinline__ void gemm_phase(PG8_LAS unsigned char* lds, const Gemm g, const Sched& S, const Epi& E) {
    const int tid = threadIdx.x, wid = __builtin_amdgcn_readfirstlane(tid >> 6), lane = tid & 63, wr = wid >> 2, wc = wid & 3, fr = lane & 15, fq = lane >> 4;
    const int K = g.K, nt = K / BK;
    unsigned voffA[2], voffB[2];
#pragma unroll
    for (int i = 0; i < 2; ++i) { int R, C; stage_rc(tid * 16 + i * 8192, R, C); const int Rb = Epi::PERM ? ((R & ~31) + perm32(R & 31)) : R;
        voffA[i] = (unsigned)(R * g.lda + C) * 2u; voffB[i] = (unsigned)(Rb * g.ldb + C) * 2u; }
    const size_t kstep = (size_t)(BK * 2);
    const size_t hstepA = (size_t)HALF * g.lda * 2, hstepB = (size_t)HALF * g.ldb * 2;
    const size_t tstepA = 2 * hstepA, tstepB = 2 * hstepB;
    const unsigned ldsw = (unsigned)wid * 1024u;
    const int aoff = lds_byte(wr * 64 + fr, fq * 8), boff = lds_byte(wc * 32 + fr, fq * 8);
#define PG8_SA(b, h) (((b) * 2 + (h)) * HTB)
#define PG8_SB(b, h) ((4 + (b) * 2 + (h)) * HTB)
#define PG8_STAGE(bufoff, gbase, voff) do { _Pragma("unroll") for (int _i = 0; _i < 2; ++_i) \
        __builtin_amdgcn_global_load_lds((const unsigned*)((const char*)(gbase) + (voff)[_i]), (PG8_LAS unsigned*)(lds + (bufoff) + ldsw + _i * 8192), 16, 0, 0); } while (0)
#define PG8_LDA(dst, b, h) do { _Pragma("unroll") for (int m = 0; m < 4; ++m) { if constexpr (FP8) dst##8[m] = cat8(*(const PG8_LAS bf16x8*)(lds + PG8_SA(b, h) + aoff + m * 2048), *(const PG8_LAS bf16x8*)(lds + PG8_SA(b, h) + aoff + m * 2048 + 1024)); \
        else { _Pragma("unroll") for (int k = 0; k < 2; ++k) dst[m][k] = *(const PG8_LAS bf16x8*)(lds + PG8_SA(b, h) + aoff + m * 2048 + k * 1024); } } } while (0)
#define PG8_LDB(dst, b, h) do { _Pragma("unroll") for (int n = 0; n < 2; ++n) { if constexpr (FP8) dst##8[n] = cat8(*(const PG8_LAS bf16x8*)(lds + PG8_SB(b, h) + boff + n * 2048), *(const PG8_LAS bf16x8*)(lds + PG8_SB(b, h) + boff + n * 2048 + 1024)); \
        else { _Pragma("unroll") for (int k = 0; k < 2; ++k) dst[n][k] = *(const PG8_LAS bf16x8*)(lds + PG8_SB(b, h) + boff + n * 2048 + k * 1024); } } } while (0)
#define PG8_MMA(ai, bj, At, Bt) do { __builtin_amdgcn_s_setprio(1); _Pragma("unroll") for (int m = 0; m < 4; ++m) _Pragma("unroll") for (int n = 0; n < 2; ++n) { \
        if constexpr (FP8) asm volatile("v_mfma_scale_f32_16x16x128_f8f6f4 %0, %1, %2, %0, %3, %3 op_sel_hi:[0,0,0]" : "+v"(acc[ai][bj][m][n]) : "v"(Bt##8[n]), "v"(At##8[m]), "v"(fp8_unit_scale)); \
        else { _Pragma("unroll") for (int k = 0; k < 2; ++k) acc[ai][bj][m][n] = __builtin_amdgcn_mfma_f32_16x16x32_bf16(Bt[n][k], At[m][k], acc[ai][bj][m][n], 0, 0, 0); } } __builtin_amdgcn_s_setprio(0); } while (0)
#define PG8_WAIT_V(n) asm volatile("s_waitcnt vmcnt(" #n ")" ::: "memory")
#define PG8_WAIT_L(n) asm volatile("s_waitcnt lgkmcnt(" #n ")" ::: "memory")
#define PG8_BAR __builtin_amdgcn_s_barrier()
#define PG8_SCHED __builtin_amdgcn_sched_barrier(0)
    Unit cur, nxt; int ui = 0;
    if (!S.next(0, cur)) return;
    f32x4 acc[2][2][4][2];
#pragma unroll
    for (int a = 0; a < 2; ++a)
#pragma unroll
        for (int b = 0; b < 2; ++b)
#pragma unroll
            for (int m = 0; m < 4; ++m)
#pragma unroll
                for (int n = 0; n < 2; ++n) acc[a][b][m][n] = (f32x4){0.f, 0.f, 0.f, 0.f};
    int fp8_unit_scale = 0x7F7F7F7F; asm volatile("" : "+v"(fp8_unit_scale));
    bf16x8 At[4][2], B0[2][2], B1[2][2];
    i32x8 At8[4], B08[2], B18[2];
    const char* cA = (const char*)g.A + (size_t)cur.pm * tstepA; const char* cB = (const char*)g.Bt + (size_t)cur.pn * tstepB;
    S.a_ready(cur);
    if constexpr (SP2) {
        PG8_STAGE(PG8_SB(0, 0), cB, voffB); PG8_STAGE(PG8_SB(0, 1), cB + hstepB, voffB); PG8_STAGE(PG8_SA(0, 0), cA, voffA); PG8_STAGE(PG8_SA(0, 1), cA + hstepA, voffA);
        if (wr == 1) PG8_BAR;
        PG8_WAIT_V(2); PG8_BAR;
        PG8_STAGE(PG8_SB(1, 0), cB + kstep, voffB); PG8_STAGE(PG8_SA(1, 0), cA + kstep, voffA); PG8_STAGE(PG8_SB(1, 1), cB + hstepB + kstep, voffB);
        PG8_WAIT_V(6); PG8_BAR;
    } else {
        PG8_STAGE(PG8_SB(0, 0), cB, voffB); PG8_STAGE(PG8_SA(0, 0), cA, voffA); PG8_STAGE(PG8_SB(0, 1), cB + hstepB, voffB); PG8_STAGE(PG8_SA(0, 1), cA + hstepA, voffA);
        if (wr == 1) PG8_BAR;
        PG8_WAIT_V(4); PG8_BAR;
        PG8_STAGE(PG8_SB(1, 0), cB + kstep, voffB); PG8_STAGE(PG8_SA(1, 0), cA + kstep, voffA); PG8_STAGE(PG8_SB(1, 1), cB + hstepB + kstep, voffB);
        PG8_WAIT_V(6); PG8_BAR;
    }
    for (;;) {
        const bool has_next = S.next(ui + 1, nxt);
        const char* nA = has_next ? (const char*)g.A + (size_t)nxt.pm * tstepA : cA; const char* nB = has_next ? (const char*)g.Bt + (size_t)nxt.pn * tstepB : cB;
        for (int t = 0; t < nt; t += 2) {
            const bool last = (t == nt - 2);
            const char* a1 = cA + (size_t)(t + 1) * kstep;
            const char* a2 = last ? nA : cA + (size_t)(t + 2) * kstep; const char* b2 = last ? nB : cB + (size_t)(t + 2) * kstep;
            const char* a3 = a2 + kstep; const char* b3 = b2 + kstep;
            if (last && has_next) S.a_ready(nxt);
            if constexpr (SP2) {
            if constexpr (Epi::MID > 0) { if (t != 0 && (t % Epi::MID) == 0) { PG8_SCHED; if constexpr (FP8) asm volatile("s_nop 7\n\ts_nop 7" ::: "memory"); E.mid(acc, cur, t / Epi::MID, wr, wc, fr, fq); if constexpr (FP8) asm volatile("s_nop 7" ::: "memory"); PG8_SCHED; } }
            PG8_LDB(B0, 0, 0); PG8_LDB(B1, 0, 1); PG8_SCHED; PG8_LDA(At, 0, 0); PG8_STAGE(PG8_SA(1, 1), a1 + hstepA, voffA);
            PG8_WAIT_V(8); PG8_WAIT_L(0); PG8_BAR; PG8_MMA(0, 0, At, B0); PG8_MMA(0, 1, At, B1); PG8_BAR; PG8_SCHED;
            PG8_LDA(At, 0, 1); PG8_STAGE(PG8_SB(0, 0), b2, voffB); PG8_STAGE(PG8_SB(0, 1), b2 + hstepB, voffB); PG8_STAGE(PG8_SA(0, 0), a2, voffA);
            PG8_WAIT_V(8); PG8_WAIT_L(0); PG8_BAR; PG8_MMA(1, 0, At, B0); PG8_MMA(1, 1, At, B1); PG8_BAR; PG8_SCHED;
            PG8_LDB(B0, 1, 0); PG8_LDB(B1, 1, 1); PG8_SCHED; PG8_LDA(At, 1, 0); PG8_STAGE(PG8_SA(0, 1), a2 + hstepA, voffA);
            PG8_WAIT_V(8); PG8_WAIT_L(0); PG8_BAR; PG8_MMA(0, 0, At, B0); PG8_MMA(0, 1, At, B1); PG8_BAR; PG8_SCHED;
            PG8_LDA(At, 1, 1); PG8_STAGE(PG8_SB(1, 0), b3, voffB); PG8_STAGE(PG8_SB(1, 1), b3 + hstepB, voffB); PG8_STAGE(PG8_SA(1, 0), a3, voffA);
            PG8_WAIT_V(8); PG8_WAIT_L(0); PG8_BAR; PG8_MMA(1, 0, At, B0); PG8_MMA(1, 1, At, B1); PG8_BAR; PG8_SCHED;
            } else {
            PG8_LDB(B0, 0, 0); PG8_SCHED; PG8_LDA(At, 0, 0); PG8_STAGE(PG8_SA(1, 1), a1 + hstepA, voffA);
            PG8_WAIT_L(8); PG8_BAR; PG8_WAIT_L(0); PG8_MMA(0, 0, At, B0); PG8_BAR; PG8_SCHED;
            PG8_LDB(B1, 0, 1); PG8_STAGE(PG8_SB(0, 0), b2, voffB);
            PG8_BAR; PG8_WAIT_L(0); PG8_MMA(0, 1, At, B1); PG8_BAR;
            PG8_LDA(At, 0, 1); PG8_STAGE(PG8_SA(0, 0), a2, voffA);
            PG8_BAR; PG8_WAIT_L(0); PG8_MMA(1, 0, At, B0); PG8_BAR; PG8_SCHED;
            PG8_STAGE(PG8_SB(0, 1), b2 + hstepB, voffB);
            PG8_WAIT_V(6); PG8_BAR; PG8_MMA(1, 1, At, B1); PG8_BAR;
            PG8_LDB(B0, 1, 0); PG8_SCHED; PG8_LDA(At, 1, 0); PG8_STAGE(PG8_SA(0, 1), a2 + hstepA, voffA);
            PG8_WAIT_L(8); PG8_BAR; PG8_WAIT_L(0); PG8_MMA(0, 0, At, B0); PG8_BAR; PG8_SCHED;
            PG8_LDB(B1, 1, 1); PG8_STAGE(PG8_SB(1, 0), b3, voffB);
            PG8_BAR; PG8_WAIT_L(0); PG8_MMA(0, 1, At, B1); PG8_BAR;
            PG8_LDA(At, 1, 1); PG8_STAGE(PG8_SA(1, 0), a3, voffA);
            PG8_BAR; PG8_WAIT_L(0); PG8_MMA(1, 0, At, B0); PG8_BAR; PG8_SCHED;
            PG8_STAGE(PG8_SB(1, 1), b3 + hstepB, voffB);
            PG8_WAIT_V(6); PG8_BAR; PG8_MMA(1, 1, At, B1); PG8_BAR;
            }
        }
        if constexpr (ALIGN_EPI) { if (wr == 0) PG8_BAR; }
        if constexpr (FP8) asm volatile("s_nop 7\n\ts_nop 7" ::: "memory");
        if constexpr (!Epi::AFTER_DRAIN) { E(acc, cur, wr, wc, fr, fq); S.done(cur); }
        if (!has_next) break;
#pragma unroll
        for (int a = 0; a < 2; ++a)
#pragma unroll
            for (int b = 0; b < 2; ++b)
#pragma unroll
                for (int m = 0; m < 4; ++m)
#pragma unroll
                    for (int n = 0; n < 2; ++n) acc[a][b][m][n] = (f32x4){0.f, 0.f, 0.f, 0.f};
        cur = nxt; cA = nA; cB = nB; ++ui;
        if constexpr (ALIGN_EPI) { if (wr == 1) PG8_BAR; }
    }
    PG8_WAIT_V(0);
    if constexpr (!ALIGN_EPI) { if (wr == 0) PG8_BAR; }
    PG8_BAR;
    if constexpr (Epi::AFTER_DRAIN) { E.fused(acc, cur, wr, wc, fr, fq, lds, wid, lane); S.done(cur); }
#undef PG8_SA
#undef PG8_SB
#undef PG8_STAGE
#undef PG8_LDA
#undef PG8_LDB
#undef PG8_MMA
#undef PG8_WAIT_V
#undef PG8_WAIT_L
#undef PG8_BAR
#undef PG8_SCHED
}
template <class Epi, class Sched, bool FP8 = false>
__device__ __forceinline__ void gemm_phase_gather(PG8_LAS unsigned char* lds, const Gemm g, const Sched& S, const Epi& E) {
    const int tid = threadIdx.x, wid = __builtin_amdgcn_readfirstlane(tid >> 6), lane = tid & 63, wr = wid >> 2, wc = wid & 3, fr = lane & 15, fq = lane >> 4;
    const int K = g.K, nt = K / BK;
    unsigned voffB[2]; int RA[2], CA[2];
#pragma unroll
    for (int i = 0; i < 2; ++i) { int R, C; stage_rc(tid * 16 + i * 8192, R, C); const int Rb = Epi::PERM ? ((R & ~31) + perm32(R & 31)) : R;
        RA[i] = R; CA[i] = C; voffB[i] = (unsigned)(Rb * g.ldb + C) * 2u; }
    const size_t kstep = (size_t)(BK * 2);
    const size_t hstepB = (size_t)HALF * g.ldb * 2, tstepB = 2 * hstepB;
    const unsigned ldsw = (unsigned)wid * 1024u;
    const int aoff = lds_byte(wr * 64 + fr, fq * 8), boff = lds_byte(wc * 32 + fr, fq * 8);
#define PG8_SA(b, h) (((b) * 2 + (h)) * HTB)
#define PG8_SB(b, h) ((4 + (b) * 2 + (h)) * HTB)
#define PG8_STAGE(bufoff, gbase, voff) do { _Pragma("unroll") for (int _i = 0; _i < 2; ++_i) \
        __builtin_amdgcn_global_load_lds((const unsigned*)((const char*)(gbase) + (voff)[_i]), (PG8_LAS unsigned*)(lds + (bufoff) + ldsw + _i * 8192), 16, 0, 0); } while (0)
#define PG8_LDA(dst, b, h) do { _Pragma("unroll") for (int m = 0; m < 4; ++m) { if constexpr (FP8) dst##8[m] = cat8(*(const PG8_LAS bf16x8*)(lds + PG8_SA(b, h) + aoff + m * 2048), *(const PG8_LAS bf16x8*)(lds + PG8_SA(b, h) + aoff + m * 2048 + 1024)); \
        else { _Pragma("unroll") for (int k = 0; k < 2; ++k) dst[m][k] = *(const PG8_LAS bf16x8*)(lds + PG8_SA(b, h) + aoff + m * 2048 + k * 1024); } } } while (0)
#define PG8_LDB(dst, b, h) do { _Pragma("unroll") for (int n = 0; n < 2; ++n) { if constexpr (FP8) dst##8[n] = cat8(*(const PG8_LAS bf16x8*)(lds + PG8_SB(b, h) + boff + n * 2048), *(const PG8_LAS bf16x8*)(lds + PG8_SB(b, h) + boff + n * 2048 + 1024)); \
        else { _Pragma("unroll") for (int k = 0; k < 2; ++k) dst[n][k] = *(const PG8_LAS bf16x8*)(lds + PG8_SB(b, h) + boff + n * 2048 + k * 1024); } } } while (0)
#define PG8_MMA(ai, bj, At, Bt) do { __builtin_amdgcn_s_setprio(1); _Pragma("unroll") for (int m = 0; m < 4; ++m) _Pragma("unroll") for (int n = 0; n < 2; ++n) { \
        if constexpr (FP8) asm volatile("v_mfma_scale_f32_16x16x128_f8f6f4 %0, %1, %2, %0, %3, %3 op_sel_hi:[0,0,0]" : "+v"(acc[ai][bj][m][n]) : "v"(Bt##8[n]), "v"(At##8[m]), "v"(fp8_unit_scale)); \
        else { _Pragma("unroll") for (int k = 0; k < 2; ++k) acc[ai][bj][m][n] = __builtin_amdgcn_mfma_f32_16x16x32_bf16(Bt[n][k], At[m][k], acc[ai][bj][m][n], 0, 0, 0); } } __builtin_amdgcn_s_setprio(0); } while (0)
#define PG8_WAIT_V(n) asm volatile("s_waitcnt vmcnt(" #n ")" ::: "memory")
#define PG8_WAIT_L(n) asm volatile("s_waitcnt lgkmcnt(" #n ")" ::: "memory")
#define PG8_BAR __builtin_amdgcn_s_barrier()
#define PG8_SCHED __builtin_amdgcn_sched_barrier(0)
#define PG8_ROWS(dst, ui_) do { _Pragma("unroll") for (int _h = 0; _h < 2; ++_h) _Pragma("unroll") for (int _i = 0; _i < 2; ++_i) \
        dst[_h][_i] = (unsigned)S.row_token((ui_), _h * HALF + RA[_i]) * (unsigned)(g.lda * 2) + (unsigned)(CA[_i] * 2); } while (0)
    Unit cur, nxt; int ui = 0;
    if (!S.next(0, cur)) return;
    f32x4 acc[2][2][4][2];
#pragma unroll
    for (int a = 0; a < 2; ++a)
#pragma unroll
        for (int b = 0; b < 2; ++b)
#pragma unroll
            for (int m = 0; m < 4; ++m)
#pragma unroll
                for (int n = 0; n < 2; ++n) acc[a][b][m][n] = (f32x4){0.f, 0.f, 0.f, 0.f};
    int fp8_unit_scale = 0x7F7F7F7F; asm volatile("" : "+v"(fp8_unit_scale));
    bf16x8 At[4][2], B0[2][2], B1[2][2];
    i32x8 At8[4], B08[2], B18[2];
    unsigned offC[2][2];
    PG8_ROWS(offC, 0);
    const char* gA = (const char*)g.A;
    const char* cB = (const char*)g.Bt + (size_t)cur.pn * tstepB;
    PG8_STAGE(PG8_SB(0, 0), cB, voffB); PG8_STAGE(PG8_SB(0, 1), cB + hstepB, voffB); PG8_STAGE(PG8_SA(0, 0), gA, offC[0]); PG8_STAGE(PG8_SA(0, 1), gA, offC[1]);
    if (wr == 1) PG8_BAR;
    PG8_WAIT_V(2); PG8_BAR;
    PG8_STAGE(PG8_SB(1, 0), cB + kstep, voffB); PG8_STAGE(PG8_SA(1, 0), gA + kstep, offC[0]); PG8_STAGE(PG8_SB(1, 1), cB + hstepB + kstep, voffB);
    PG8_WAIT_V(6); PG8_BAR;
    for (;;) {
        const bool has_next = S.next(ui + 1, nxt);
        const char* nB = has_next ? (const char*)g.Bt + (size_t)nxt.pn * tstepB : cB;
        for (int t = 0; t < nt; t += 2) {
            const bool last = (t == nt - 2);
            const char* a1 = gA + (size_t)(t + 1) * kstep;
            const char* a2 = last ? gA : gA + (size_t)(t + 2) * kstep; const char* b2 = last ? nB : cB + (size_t)(t + 2) * kstep;
            const char* a3 = a2 + kstep; const char* b3 = b2 + kstep;
            PG8_LDB(B0, 0, 0); PG8_LDB(B1, 0, 1); PG8_SCHED; PG8_LDA(At, 0, 0); PG8_STAGE(PG8_SA(1, 1), a1, offC[1]);
            if (last && has_next) { PG8_ROWS(offC, ui + 1); }
            PG8_WAIT_V(8); PG8_WAIT_L(0); PG8_BAR; PG8_MMA(0, 0, At, B0); PG8_MMA(0, 1, At, B1); PG8_BAR; PG8_SCHED;
            PG8_LDA(At, 0, 1); PG8_STAGE(PG8_SB(0, 0), b2, voffB); PG8_STAGE(PG8_SB(0, 1), b2 + hstepB, voffB); PG8_STAGE(PG8_SA(0, 0), a2, offC[0]);
            PG8_WAIT_V(8); PG8_WAIT_L(0); PG8_BAR; PG8_MMA(1, 0, At, B0); PG8_MMA(1, 1, At, B1); PG8_BAR; PG8_SCHED;
            PG8_LDB(B0, 1, 0); PG8_LDB(B1, 1, 1); PG8_SCHED; PG8_LDA(At, 1, 0); PG8_STAGE(PG8_SA(0, 1), a2, offC[1]);
            PG8_WAIT_V(8); PG8_WAIT_L(0); PG8_BAR; PG8_MMA(0, 0, At, B0); PG8_MMA(0, 1, At, B1); PG8_BAR; PG8_SCHED;
            PG8_LDA(At, 1, 1); PG8_STAGE(PG8_SB(1, 0), b3, voffB); PG8_STAGE(PG8_SB(1, 1), b3 + hstepB, voffB); PG8_STAGE(PG8_SA(1, 0), a3, offC[0]);
            PG8_WAIT_V(8); PG8_WAIT_L(0); PG8_BAR; PG8_MMA(1, 0, At, B0); PG8_MMA(1, 1, At, B1); PG8_BAR; PG8_SCHED;
        }
        if (wr == 0) PG8_BAR;
        if constexpr (FP8) asm volatile("s_nop 7\n\ts_nop 7" ::: "memory");
        E(acc, cur, wr, wc, fr, fq); S.done(cur);
        if (!has_next) break;
#pragma unroll
        for (int a = 0; a < 2; ++a)
#pragma unroll
            for (int b = 0; b < 2; ++b)
#pragma unroll
                for (int m = 0; m < 4; ++m)
#pragma unroll
                    for (int n = 0; n < 2; ++n) acc[a][b][m][n] = (f32x4){0.f, 0.f, 0.f, 0.f};
        cur = nxt; cB = nB; ++ui;
        if (wr == 1) PG8_BAR;
    }
    PG8_WAIT_V(0);
    PG8_BAR;
#undef PG8_ROWS
#undef PG8_SA
#undef PG8_SB
#undef PG8_STAGE
#undef PG8_LDA
#undef PG8_LDB
#undef PG8_MMA
#undef PG8_WAIT_V
#undef PG8_WAIT_L
#undef PG8_BAR
#undef PG8_SCHED
}
}

#ifndef MERGE_FP8
#define MERGE_FP8 1
#endif
#ifndef MOE_DN_FP8
#define MOE_DN_FP8 1
#endif
#ifndef MOE_UP_FP8
#define MOE_UP_FP8 1
#endif
#ifndef PROBE_NOATOM
#define PROBE_NOATOM 0
#endif
constexpr int T = 8192, D = 2048, NL = 2, BW = 512, ZC = 14336, INC = 14352;
constexpr int NE = 64, NEX = 65  , ED = 512;
constexpr int BRW = 4 * BW;
constexpr int HK = NEX * ED;
constexpr float ALPHA = 1.41421356237f;
constexpr float LN_EPS = 1e-5f;
constexpr float UPSC = MOE_UP_FP8 ? (1.f / 64.f) : 1.f;
constexpr float BRSC = MERGE_FP8 ? 8.f : 1.f, MGSC = MERGE_FP8 ? (1.f / (8.f * 64.f)) : 1.f;
constexpr float HSC = 8.f, DNSC = MOE_DN_FP8 ? (1.f / (HSC * 64.f)) : 1.f;
constexpr int ZC_SBQ = 0, ZC_SBK = 512, ZC_SBV = 1024, ZC_GMU = 1536, ZC_GMV = 2048, ZC_GDN = 2560, ZC_GDNG = 4096,
              ZC_MLQ = 4608, ZC_MLK = 4864, ZC_MLV = 5120, ZC_MLO = 5632, ZC_GATE = 6144;

#define GAS __attribute__((address_space(1)))
#define LAS __attribute__((address_space(3)))
typedef unsigned short bf16;
typedef unsigned v4u __attribute__((ext_vector_type(4)));
typedef unsigned v2u __attribute__((ext_vector_type(2)));
typedef float v4f __attribute__((ext_vector_type(4)));
typedef float v2f __attribute__((ext_vector_type(2)));
#define LDS_WAIT() asm volatile("s_waitcnt lgkmcnt(0)" ::: "memory")
#define LDS_BAR() do { asm volatile("s_waitcnt lgkmcnt(0)" ::: "memory"); __builtin_amdgcn_s_barrier(); asm volatile("" ::: "memory"); } while (0)

constexpr size_t MiB = 1u << 20;
constexpr size_t WS_CTL = 0, CTL_ZERO_BYTES = 1 * MiB;
constexpr size_t WS_WIN = 2 * MiB, WS_WBR = 58 * MiB, WS_WOUT = 66 * MiB, WS_WUP = 74 * MiB, WS_WDN = 334 * MiB;
constexpr size_t WS_XB = 464 * MiB, WS_SMALL = 496 * MiB, WS_EG = 497 * MiB, WS_BETA = WS_EG + 256 * 1024, WS_COMB = 498 * MiB;
constexpr size_t WS_Z = 500 * MiB, WS_GQ = 724 * MiB, WS_GK = 740 * MiB, WS_GV = 756 * MiB, WS_GO = 772 * MiB, WS_HO = 788 * MiB;
constexpr size_t WS_BR = 804 * MiB, WS_MTMP = 836 * MiB, WS_MSUM = 900 * MiB, WS_Y = 932 * MiB, WS_X1 = 996 * MiB, WS_X1B = 1060 * MiB;
constexpr size_t WS_XCUR = 1092 * MiB, WS_HB = 1156 * MiB, WS_YEXP = 1236 * MiB, WS_LIST = 1524 * MiB, WS_WL = 1526 * MiB, WS_SLOT = 1528 * MiB, WS_MQ = 1530 * MiB, WS_MS = 1534 * MiB, WS_MK = 1538 * MiB, WS_MV = 1542 * MiB, WS_MFL = 1552 * MiB, WS_HDEN = WS_MFL + 65536, WS_VT = 1553 * MiB, WS_END = 1561 * MiB;
constexpr size_t WS_GU = WS_GQ, WS_GNW = WS_GK, WS_GQG = WS_GK + 8 * MiB, WS_GKT = WS_GV, WS_GAT = WS_GV + 8 * MiB, WS_GDL = WS_GV + 12 * MiB;
constexpr int HROWS = 73728;
static_assert(WS_HB + (size_t)HROWS * ED * 2 <= WS_YEXP && WS_YEXP + (size_t)HROWS * D * 2 <= WS_LIST, "ws map (moe)");
static_assert(WS_WIN + (size_t)ZC * D * 2 <= WS_WBR && WS_WUP + (size_t)NEX * 1024 * D * 2 <= WS_WDN && WS_WDN + (size_t)D * HK * 2 <= WS_XB, "ws map (weights)");
static_assert(WS_Z + (size_t)T * ZC * 2 <= WS_GQ, "ws map (acts)");
constexpr int CW_BAR = 4096, CW_CNT = 16384;
constexpr int TAB_OFF = 131072 + 1024;
constexpr int LDS_BYTES = 163840, MISC_OFF = 131072 + 320;

__device__ __forceinline__ float bflo(unsigned w) { return __uint_as_float(w << 16); }
__device__ __forceinline__ float bfhi(unsigned w) { return __uint_as_float(w & 0xffff0000u); }
__device__ __forceinline__ unsigned f2bf(float f) { unsigned u = __float_as_uint(f); return (u + 0x7fffu + ((u >> 16) & 1u)) >> 16; }
__device__ __forceinline__ unsigned pk2(float lo, float hi) { return f2bf(lo) | (f2bf(hi) << 16); }
__device__ __forceinline__ unsigned pk4_f8(float a, float b, float c, float d, float sc) {
    a = __builtin_amdgcn_fmed3f(a * sc, -448.f, 448.f); b = __builtin_amdgcn_fmed3f(b * sc, -448.f, 448.f); c = __builtin_amdgcn_fmed3f(c * sc, -448.f, 448.f); d = __builtin_amdgcn_fmed3f(d * sc, -448.f, 448.f);
    unsigned w = 0; w = __builtin_amdgcn_cvt_pk_fp8_f32(a, b, w, false); w = __builtin_amdgcn_cvt_pk_fp8_f32(c, d, w, true); return w; }
__device__ __forceinline__ v4f ld4(const void* base, size_t idx, bool is_bf16) {
    if (is_bf16) { const v2u r = *(const v2u*)((const unsigned short*)base + idx); return (v4f){bflo(r.x), bfhi(r.x), bflo(r.y), bfhi(r.y)}; }
    return *(const v4f*)((const float*)base + idx); }
template <int CTRL> __device__ __forceinline__ float dpp(float x) { return __builtin_bit_cast(float, __builtin_amdgcn_mov_dpp(__builtin_bit_cast(int, x), CTRL, 0xf, 0xf, true)); }
__device__ __forceinline__ float sum4(float x) { x += dpp<0xB1>(x); x += dpp<0x4E>(x); return x; }
__device__ __forceinline__ float sum8(float x) { x = sum4(x); x += dpp<0x141>(x); return x; }
__device__ __forceinline__ float sum16(float x) { x = sum8(x); x += dpp<0x140>(x); return x; }
__device__ __forceinline__ float wave_sum(float x) { x = sum16(x); x += __shfl_xor(x, 16); x += __shfl_xor(x, 32); return x; }
__device__ __forceinline__ float max8(float x) { x = fmaxf(x, dpp<0xB1>(x)); x = fmaxf(x, dpp<0x4E>(x)); x = fmaxf(x, dpp<0x141>(x)); return x; }
__device__ __forceinline__ float min8(float x) { x = fminf(x, dpp<0xB1>(x)); x = fminf(x, dpp<0x4E>(x)); x = fminf(x, dpp<0x141>(x)); return x; }
__device__ __forceinline__ float wave_scan_incl(float v) {
    v += __builtin_bit_cast(float, __builtin_amdgcn_update_dpp(0, __builtin_bit_cast(int, v), 0x111, 0xf, 0xf, true));
    v += __builtin_bit_cast(float, __builtin_amdgcn_update_dpp(0, __builtin_bit_cast(int, v), 0x112, 0xf, 0xf, true));
    v += __builtin_bit_cast(float, __builtin_amdgcn_update_dpp(0, __builtin_bit_cast(int, v), 0x114, 0xf, 0xf, true));
    v += __builtin_bit_cast(float, __builtin_amdgcn_update_dpp(0, __builtin_bit_cast(int, v), 0x118, 0xf, 0xf, true));
    v += __builtin_bit_cast(float, __builtin_amdgcn_update_dpp(0, __builtin_bit_cast(int, v), 0x142, 0xa, 0xf, false));
    v += __builtin_bit_cast(float, __builtin_amdgcn_update_dpp(0, __builtin_bit_cast(int, v), 0x143, 0xc, 0xf, false));
    return v;
}
__device__ __forceinline__ float sigmoidf_(float x) { return 1.f / (1.f + __expf(-x)); }
__device__ __forceinline__ float siluf_(float x) { return x / (1.f + __expf(-x)); }
__device__ __forceinline__ float softplusf_(float x) { return fmaxf(x, 0.f) + __logf(1.f + __expf(-fabsf(x))); }
__device__ __forceinline__ float gelu_tanh(float x) { const float y = 0.7978845608f * (x + 0.044715f * x * x * x); const float t = 1.f - 2.f / (__expf(2.f * y) + 1.f); return 0.5f * x * (1.f + t); }
__device__ __forceinline__ void unpack8(const v4u r, float (&f)[8]) { f[0] = bflo(r.x); f[1] = bfhi(r.x); f[2] = bflo(r.y); f[3] = bfhi(r.y); f[4] = bflo(r.z); f[5] = bfhi(r.z); f[6] = bflo(r.w); f[7] = bfhi(r.w); }
#define XB_TMO      128
#define XB_XCNT(j)  (256  + 64 * (j))
#define XB_XSUB(j)  (1280 + 64 * (j))
#define XB_XGEN(j)  (2304 + 64 * (j))
#define XB_TOP      3328
#define XB_TOPGEN   3392
#define XCD_BAR_WORDS 3456
#define XB_SPIN_CAP (1u << 18)

__device__ __forceinline__ unsigned xb_ld(unsigned* p)              { return __hip_atomic_load(p, __ATOMIC_RELAXED, __HIP_MEMORY_SCOPE_AGENT); }
__device__ __forceinline__ unsigned xb_add(unsigned* p, unsigned v) { return __hip_atomic_fetch_add(p, v, __ATOMIC_RELAXED, __HIP_MEMORY_SCOPE_AGENT); }
__device__ __forceinline__ unsigned xb_xcc_id() { return (unsigned)__builtin_amdgcn_s_getreg((3 << 11) | 20) & 0xFu; }
#define XB_SPIN(cond, bar) do { unsigned _sp = 0; while (cond) { __builtin_amdgcn_s_sleep(1); \
    if ((++_sp & 255u) == 0u) { if (xb_ld(&(bar)[XB_TMO])) break; if (_sp > XB_SPIN_CAP) { atomicAdd(&(bar)[XB_TMO], 1u); break; } } } } while (0)

struct XcdBarrier {
    unsigned* bar; unsigned x;
    volatile LAS unsigned* st;
};

__device__ __forceinline__ XcdBarrier xcd_barrier_post(unsigned* bar, volatile LAS unsigned* st) {
    XcdBarrier b; b.bar = bar; b.x = xb_xcc_id(); b.st = st;
    if (threadIdx.x == 0) (void)xb_add(&bar[XB_XCNT(b.x)], 1u);
    return b;
}
__device__ __forceinline__ void xcd_barrier_complete(unsigned* bar, unsigned x, unsigned& nloc, unsigned& nx) {
    const unsigned G = gridDim.x * gridDim.y * gridDim.z;
    unsigned sum, cnt, mine, sp = 0u;
    for (;;) {
        sum = 0u; cnt = 0u; mine = 0u;
#pragma unroll
        for (unsigned j = 0; j < 16; ++j) { const unsigned c = xb_ld(&bar[XB_XCNT(j)]); sum += c; cnt += (c > 0u) ? 1u : 0u; mine = (j == x) ? c : mine; }
        if (sum == G) break;
        __builtin_amdgcn_s_sleep(1);
        if ((++sp & 255u) == 0u) { if (xb_ld(&bar[XB_TMO])) break; if (sp > XB_SPIN_CAP) { atomicAdd(&bar[XB_TMO], 1u); break; } }
    }
    nloc = mine > 0u ? mine : 1u; nx = cnt > 0u ? cnt : 1u;
}

__device__ __forceinline__ void xcd_barrier(const XcdBarrier& b) {
    asm volatile("s_waitcnt vmcnt(0)" ::: "memory");
    __syncthreads();
    if (threadIdx.x == 0) {
        unsigned* bar = b.bar;
        __builtin_amdgcn_s_waitcnt(0);
        unsigned nloc = b.st[0], nx = b.st[1];
        if (nloc == 0u) { xcd_barrier_complete(bar, b.x, nloc, nx); b.st[0] = nloc; b.st[1] = nx; }
        const unsigned old = xb_add(&bar[XB_XSUB(b.x)], 1u);
        const unsigned gen = old / nloc;
        if (old + 1u == (gen + 1u) * nloc) {
            __builtin_amdgcn_fence(__ATOMIC_RELEASE, "agent");
            asm volatile("s_waitcnt vmcnt(0)" ::: "memory");
            const unsigned og = xb_add(&bar[XB_TOP], 1u);
            const unsigned tg = og / nx;
            if (og + 1u == (tg + 1u) * nx) xb_add(&bar[XB_TOPGEN], 1u);
            else XB_SPIN(xb_ld(&bar[XB_TOPGEN]) == tg, bar);
            __builtin_amdgcn_fence(__ATOMIC_ACQUIRE, "agent");
            xb_add(&bar[XB_XGEN(b.x)], 1u);
            asm volatile("s_waitcnt vmcnt(0)" ::: "memory");
        } else {
            XB_SPIN(xb_ld(&bar[XB_XGEN(b.x)]) == gen, bar);
            __builtin_amdgcn_fence(__ATOMIC_ACQUIRE, "agent");
            asm volatile("s_waitcnt vmcnt(0)" ::: "memory");
        }
    }
    __syncthreads();
}

struct Params { const float* in[27]; float* out; unsigned char* ws; int ph_lo, ph_hi; };
enum { I_X = 0, I_WIN, I_GMNG, I_GMNB, I_GMWS, I_GMBS, I_CONVW, I_ALOG, I_DTB, I_GDNNG, I_MLIB, I_MLFB, I_MLNG, I_WBR, I_WOUT, I_LN1G, I_LN1B,
       I_WR, I_RB, I_WG, I_WU, I_WD, I_SG, I_SU, I_SD, I_LN2G, I_LN2B };

using pg8::f32x4; using pg8::u32x4; using pg8::Unit; using pg8::HALF; using pg8::BM;

struct EpiMergeH {
    static constexpr bool PERM = true, AFTER_DRAIN = false; static constexpr int MID = MERGE_FP8 ? BW / (2 * pg8::BK) : BW / pg8::BK;
    const bf16* Z; bf16* msum;
    __device__ __forceinline__ void mid(f32x4 (&acc)[2][2][4][2], const Unit& u, int j, int wr, int wc, int fr, int fq) const {
        int row0 = u.pm * BM + wr * 64 + fr; const int col0 = u.pn * BM + wc * 32 + 8 * fq; asm volatile("" : "+v"(row0));
        const bf16* zp = Z + ZC_GATE + (size_t)(j - 1) * D + col0;
#pragma unroll
        for (int am = 0; am < 4; ++am) { const int ai = am >> 1, m0 = (am & 1) * 2; v4u ga[2][2], gb[2][2];
#pragma unroll
            for (int m = 0; m < 2; ++m)
#pragma unroll
                for (int bj = 0; bj < 2; ++bj) { const bf16* q = zp + (size_t)(row0 + ai * HALF + (m0 + m) * 16) * ZC + bj * HALF; ga[m][bj] = *(const v4u*)q; gb[m][bj] = *(const v4u*)(q + D); }
#pragma unroll
            for (int m = 0; m < 2; ++m)
#pragma unroll
                for (int bj = 0; bj < 2; ++bj) { float a[8], b[8]; unpack8(ga[m][bj], a); unpack8(gb[m][bj], b);
#pragma unroll
                    for (int i = 0; i < 8; ++i) { const float ea = __builtin_amdgcn_exp2f(fmaxf(a[i], -60.f) * -1.44269504f), eb = __builtin_amdgcn_exp2f(fmaxf(b[i], -60.f) * -1.44269504f);
                        acc[ai][bj][m0 + m][i >> 2][i & 3] *= (1.f + eb) * __builtin_amdgcn_rcpf(1.f + ea); } }
            asm volatile("" ::: "memory"); }
    }
    __device__ __forceinline__ void operator()(const f32x4 (&acc)[2][2][4][2], const Unit& u, int wr, int wc, int fr, int fq) const {
        const int row0 = u.pm * BM + wr * 64 + fr, col0 = u.pn * BM + wc * 32 + 8 * fq;
#pragma unroll
        for (int ai = 0; ai < 2; ++ai) { v4u gg[4][2];
#pragma unroll
            for (int m = 0; m < 4; ++m)
#pragma unroll
                for (int bj = 0; bj < 2; ++bj) gg[m][bj] = *(const v4u*)(Z + (size_t)(row0 + ai * HALF + m * 16) * ZC + ZC_GATE + 3 * D + col0 + bj * HALF);
#pragma unroll
            for (int m = 0; m < 4; ++m)
#pragma unroll
                for (int bj = 0; bj < 2; ++bj) { const size_t row = (size_t)(row0 + ai * HALF + m * 16); const int col = col0 + bj * HALF; float gl[8]; unpack8(gg[m][bj], gl);
                    f32x4 v0 = acc[ai][bj][m][0], v1 = acc[ai][bj][m][1];
#pragma unroll
                    for (int j = 0; j < 4; ++j) { v0[j] *= sigmoidf_(gl[j]) * MGSC; v1[j] *= sigmoidf_(gl[4 + j]) * MGSC; }
                    unsigned w0 = 0, w1 = 0; w0 = __builtin_amdgcn_cvt_pk_fp8_f32(v0[0], v0[1], w0, false); w0 = __builtin_amdgcn_cvt_pk_fp8_f32(v0[2], v0[3], w0, true); w1 = __builtin_amdgcn_cvt_pk_fp8_f32(v1[0], v1[1], w1, false); w1 = __builtin_amdgcn_cvt_pk_fp8_f32(v1[2], v1[3], w1, true);
                    *(v2u*)((unsigned char*)msum + row * D + col) = (v2u){w0, w1}; }
            asm volatile("" ::: "memory"); }
    }
};
struct EpiResid {
    static constexpr bool PERM = true, AFTER_DRAIN = false; static constexpr int MID = 0;
    const void* X; bf16* Y; float sc; bool xbf;
    __device__ __forceinline__ void operator()(const f32x4 (&acc)[2][2][4][2], const Unit& u, int wr, int wc, int fr, int fq) const {
        const int row0 = u.pm * BM + wr * 64 + fr, col0 = u.pn * BM + wc * 32 + 8 * fq;
#pragma unroll
        for (int ai = 0; ai < 2; ++ai)
#pragma unroll
            for (int m = 0; m < 4; ++m) { const size_t off = (size_t)(row0 + ai * HALF + m * 16) * D + col0;
#pragma unroll
                for (int bj = 0; bj < 2; ++bj) { const f32x4 x0 = ld4(X, off + bj * HALF, xbf), x1 = ld4(X, off + bj * HALF + 4, xbf);
                    const f32x4 v0 = x0 * ALPHA + acc[ai][bj][m][0] * sc, v1 = x1 * ALPHA + acc[ai][bj][m][1] * sc;
                    u32x4 w; w.x = pk2(v0[0], v0[1]); w.y = pk2(v0[2], v0[3]); w.z = pk2(v1[0], v1[1]); w.w = pk2(v1[2], v1[3]); *(u32x4*)(Y + off + bj * HALF) = w; } }
    }
};
struct MoeTab {
    LAS int* t; LAS unsigned short* tok; LAS float* wt; LAS unsigned char* mte;
    __device__ __forceinline__ MoeTab(LAS unsigned char* lds) : t((LAS int*)(lds + TAB_OFF)), tok((LAS unsigned short*)(lds + TAB_OFF + 1024)), wt((LAS float*)(lds + TAB_OFF + 5120)), mte((LAS unsigned char*)(lds + TAB_OFF + 13312)) {}
};
__device__ __forceinline__ void moe_tables(const MoeTab& M, const unsigned* cnt  , int tid, int lane, int wave) {
    __syncthreads();
    if (wave == 0) { const int c = (int)cnt[64 * lane]; const int tiles = (c + 255) >> 8; const float incl = wave_scan_incl((float)tiles);
        M.t[80 + lane] = c; M.t[lane] = (int)incl - tiles; if (lane == 63) { M.t[64] = (int)incl; M.t[65] = (int)incl + T / 256; M.t[80 + 64] = T; } }
    __syncthreads();
    const int Mt = M.t[65];
    for (int mt = tid; mt < Mt; mt += 512) { int e = 0;
        for (int k = 1; k <= 64; ++k) e = (M.t[k] <= mt) ? k : e;
        M.mte[mt] = (unsigned char)e; }
    __syncthreads();
}
struct UpOrder {
    MoeTab M; int n;
    __device__ __forceinline__ bool next(int i, Unit& u) const { if (i >= n) return false; u.pm = M.t[168 + i]; u.pn = M.t[176 + i]; u.aux = i; return true; }
    __device__ __forceinline__ int row_token(int i, int r) const { return (int)M.tok[i * 256 + r]; }
    __device__ __forceinline__ void a_ready(const Unit&) const {}
    __device__ __forceinline__ void done(const Unit&) const {}
};
__device__ __forceinline__ int up_order_build(const MoeTab& M, const int* LIST, const float* WL, int wg, int G, int tid) {
    const int U = 4 * M.t[65];
    if (tid < 8) { const int L = tid * G + wg; if (L < U) { const int mt = L >> 2, q = L & 3, e = M.mte[mt]; M.t[168 + tid] = mt; M.t[176 + tid] = e * 4 + q; M.t[184 + tid] = e; M.t[192 + tid] = mt - M.t[e]; } }
    int n = 0;
#pragma unroll
    for (int i = 0; i < 8; ++i) n += (i * G + wg < U) ? 1 : 0;
    __syncthreads();
    for (int idx = tid; idx < n * 256; idx += 512) { const int i = idx >> 8, r = idx & 255, e = M.t[184 + i], li = M.t[192 + i] * 256 + r;
        int tk = 0; float w = 0.f;
        if (e < NE) { if (li < M.t[80 + e]) { tk = LIST[e * T + li]; w = WL[e * T + li]; } } else { tk = li; w = 1.f; }
        M.tok[idx] = (unsigned short)tk; M.wt[idx] = w; }
    __syncthreads();
    return n;
}
struct EpiGluSparse {
    static constexpr bool PERM = true, AFTER_DRAIN = false; static constexpr int MID = 0;
    LAS const float* wt; bf16* H;
    __device__ __forceinline__ void operator()(const f32x4 (&acc)[2][2][4][2], const Unit& u, int wr, int wc, int fr, int fq) const {
        const int q = u.pn & 3; const int rl0 = wr * 64 + fr, col0 = q * 128 + wc * 32 + 8 * fq;
#pragma unroll
        for (int ai = 0; ai < 2; ++ai)
#pragma unroll
            for (int m = 0; m < 4; ++m) { const int rl = rl0 + ai * HALF + m * 16; const float c = wt[u.aux * 256 + rl]; float h[8];
#pragma unroll
                for (int n = 0; n < 2; ++n)
#pragma unroll
                    for (int j = 0; j < 4; ++j) h[4 * n + j] = siluf_(acc[ai][0][m][n][j] * UPSC) * (acc[ai][1][m][n][j] * UPSC) * c;
#if MOE_DN_FP8
#pragma unroll
                for (int j = 0; j < 8; ++j) h[j] = __builtin_amdgcn_fmed3f(h[j] * HSC, -448.f, 448.f);
                unsigned w0 = 0, w1 = 0; w0 = __builtin_amdgcn_cvt_pk_fp8_f32(h[0], h[1], w0, false); w0 = __builtin_amdgcn_cvt_pk_fp8_f32(h[2], h[3], w0, true); w1 = __builtin_amdgcn_cvt_pk_fp8_f32(h[4], h[5], w1, false); w1 = __builtin_amdgcn_cvt_pk_fp8_f32(h[6], h[7], w1, true);
                *(v2u*)((unsigned char*)H + ((size_t)u.pm * 256 + rl) * ED + col0) = (v2u){w0, w1}; }
#else
                u32x4 w; w.x = pk2(h[0], h[1]); w.y = pk2(h[2], h[3]); w.z = pk2(h[4], h[5]); w.w = pk2(h[6], h[7]);
                *(u32x4*)(H + ((size_t)u.pm * 256 + rl) * ED + col0) = w; }
#endif
    }
};
struct DownOrder {
    MoeTab M; int G, c, U;
    __device__ __forceinline__ bool next(int i, Unit& u) const { const int L = i * G + c; if (L >= U) return false; const int mt = L >> 3; u.pm = mt; u.pn = (int)M.mte[mt] * 8 + (L & 7); u.aux = 0; return true; }
    __device__ __forceinline__ void a_ready(const Unit&) const {}
    __device__ __forceinline__ void done(const Unit&) const {}
};
struct EpiYexp {
    static constexpr bool PERM = true, AFTER_DRAIN = false; static constexpr int MID = 0;
    bf16* Y;
    __device__ __forceinline__ void operator()(const f32x4 (&acc)[2][2][4][2], const Unit& u, int wr, int wc, int fr, int fq) const {
        const int row0 = u.pm * BM + wr * 64 + fr, col0 = (u.pn & 7) * BM + wc * 32 + 8 * fq;
#pragma unroll
        for (int ai = 0; ai < 2; ++ai)
#pragma unroll
            for (int m = 0; m < 4; ++m) { bf16* rowp = Y + (size_t)(row0 + ai * HALF + m * 16) * D + col0;
#pragma unroll
                for (int bj = 0; bj < 2; ++bj) { const f32x4 v0 = acc[ai][bj][m][0] * DNSC, v1 = acc[ai][bj][m][1] * DNSC;
                    u32x4 w; w.x = pk2(v0[0], v0[1]); w.y = pk2(v0[2], v0[3]); w.z = pk2(v1[0], v1[1]); w.w = pk2(v1[2], v1[3]); *(u32x4*)(rowp + bj * HALF) = w; } }
    }
};

struct TrItem { const float* src; bf16* dst; unsigned sld, dld; int f8; };
__device__ __forceinline__ void tr_load(const TrItem& t, int lane, v4f (&v)[8]) { const int r8 = lane >> 3, c4 = lane & 7;
#pragma unroll
    for (int i = 0; i < 8; ++i) v[i] = *(const v4f*)(t.src + (size_t)(8 * i + r8) * t.sld + 4 * c4); }
__device__ __forceinline__ void tr_store(const TrItem& t, const v4f (&v)[8], LAS float* scr, int lane, bool nostore = false) {
    { const int r8 = lane >> 3, c4 = lane & 7;
#pragma unroll
      for (int i = 0; i < 8; ++i) { LAS float* d = scr + (8 * i + r8) * 33 + 4 * c4; d[0] = v[i].x; d[1] = v[i].y; d[2] = v[i].z; d[3] = v[i].w; } }
    LDS_WAIT(); asm volatile("" ::: "memory");
    if (nostore) return;
    if (t.f8) {
        const int c = lane & 3;
#pragma unroll
        for (int j = 0; j < 2; ++j) { const int n = (lane >> 2) + 16 * j; const LAS float* s = scr + (16 * c) * 33 + n; unsigned w[4];
#pragma unroll
            for (int q = 0; q < 4; ++q) { unsigned x = 0; x = __builtin_amdgcn_cvt_pk_fp8_f32(s[(4 * q) * 33] * 64.f, s[(4 * q + 1) * 33] * 64.f, x, false); x = __builtin_amdgcn_cvt_pk_fp8_f32(s[(4 * q + 2) * 33] * 64.f, s[(4 * q + 3) * 33] * 64.f, x, true); w[q] = x; }
            *(v4u*)((unsigned char*)t.dst + (size_t)n * t.dld + 16 * c) = (v4u){w[0], w[1], w[2], w[3]}; }
    } else {
        const int c = lane & 7;
#pragma unroll
        for (int j = 0; j < 4; ++j) { const int n = (lane >> 3) + 8 * j; const LAS float* s = scr + (8 * c) * 33 + n;
            v4u o; o.x = pk2(s[0 * 33], s[1 * 33]); o.y = pk2(s[2 * 33], s[3 * 33]); o.z = pk2(s[4 * 33], s[5 * 33]); o.w = pk2(s[6 * 33], s[7 * 33]);
            *(v4u*)(t.dst + (size_t)n * t.dld + 8 * c) = o; }
    }
    LDS_WAIT(); asm volatile("" ::: "memory");
}
template <int PART> __device__ __forceinline__ TrItem tr_decode(const Params& p, int l, int it) {
    unsigned char* ws = p.ws;
    constexpr int N_IN = (ZC / 32) * (D / 64), N_BR = 4 * (BW / 64) * (D / 32), N_OUT = (D / 64) * (D / 32), N_UP = NEX * 2 * (D / 64) * (ED / 32);
    int r = it; TrItem t; t.f8 = 0;
    if (PART == 0) {
        const float* w_in = p.in[I_WIN] + (size_t)l * D * INC; const float* w_br = p.in[I_WBR] + (size_t)l * 4 * BW * D; const float* w_out = p.in[I_WOUT] + (size_t)l * D * D;
        bf16* WIN = (bf16*)(ws + WS_WIN); bf16* WBR = (bf16*)(ws + WS_WBR); bf16* WOUT = (bf16*)(ws + WS_WOUT);
        if (r < N_IN) { const int kb = r / (ZC / 32), n0 = (r % (ZC / 32)) * 32, k0 = kb * 64; const int sc = n0 + (n0 >= ZC_GATE ? 16 : (n0 >= ZC_MLQ ? 8 : 0));
            t.src = w_in + (size_t)k0 * INC + sc; t.sld = INC; t.dst = (bf16*)((unsigned char*)WIN + (size_t)n0 * D + k0); t.dld = D; t.f8 = 1; return t; } r -= N_IN;
        if (r < N_BR) { const int g = r / 512, rr = r % 512, k0 = (rr / 64) * 64, n0 = (rr % 64) * 32;
            t.src = w_br + ((size_t)g * BW + k0) * D + n0; t.sld = D;
#if MERGE_FP8
            t.dst = (bf16*)((unsigned char*)WBR + (size_t)n0 * BRW + g * BW + k0); t.dld = BRW; t.f8 = 1; return t; }
#else
            t.dst = WBR + (size_t)n0 * BRW + g * BW + k0; t.dld = BRW; return t; }
#endif
        r -= N_BR;
        { const int k0 = (r / 64) * 64, n0 = (r % 64) * 32; t.src = w_out + (size_t)k0 * D + n0; t.sld = D; t.dst = (bf16*)((unsigned char*)WOUT + (size_t)n0 * D + k0); t.dld = D; t.f8 = 1; return t; }
    } else {
        const float* w_g = p.in[I_WG] + (size_t)l * NE * D * ED; const float* w_u = p.in[I_WU] + (size_t)l * NE * D * ED; const float* w_d = p.in[I_WD] + (size_t)l * NE * ED * D;
        const float* s_g = p.in[I_SG] + (size_t)l * D * ED; const float* s_u = p.in[I_SU] + (size_t)l * D * ED; const float* s_d = p.in[I_SD] + (size_t)l * ED * D;
        bf16* WUP = (bf16*)(ws + WS_WUP); bf16* WDN = (bf16*)(ws + WS_WDN);
        if (r < N_UP) { const int e = r / 1024, rr = r % 1024, mat = rr / 512, r2 = rr % 512, k0 = (r2 / 16) * 64, n0 = (r2 % 16) * 32;
            const float* sb = (e < NE) ? ((mat ? w_u : w_g) + (size_t)e * D * ED) : (mat ? s_u : s_g);
            const int drow = e * 1024 + (n0 / 128) * 256 + mat * 128 + (n0 % 128);
            t.src = sb + (size_t)k0 * ED + n0; t.sld = ED;
#if MOE_UP_FP8
            t.dst = (bf16*)((unsigned char*)WUP + (size_t)drow * D + k0); t.dld = D; t.f8 = 1; return t; }
#else
            t.dst = WUP + (size_t)drow * D + k0; t.dld = D; return t; }
#endif
        r -= N_UP;
        { const int e = r / 512, rr = r % 512, k0 = (rr / 64) * 64, n0 = (rr % 64) * 32;
            const float* sb = (e < NE) ? (w_d + (size_t)e * ED * D) : s_d;
            t.src = sb + (size_t)k0 * D + n0; t.sld = D;
#if MOE_DN_FP8
            t.dst = (bf16*)((unsigned char*)WDN + ((size_t)e * D + n0) * ED + k0); t.dld = ED; t.f8 = 1; return t; }
#else
            t.dst = WDN + ((size_t)e * D + n0) * ED + k0; t.dld = ED; return t; }
#endif
    }
}
template <int PART> __device__ __forceinline__ void phase_convert(const Params& p, int l, LAS unsigned char* lds, int gw, int NGW, int wave, int lane, bool nostore = false) {
    constexpr int N_IN = (ZC / 32) * (D / 64), N_BR = 4 * (BW / 64) * (D / 32), N_OUT = (D / 64) * (D / 32), N_UP = NEX * 2 * (D / 64) * (ED / 32), N_DN = NEX * (ED / 64) * (D / 32);
    constexpr int NITEMS = (PART == 0) ? (N_IN + N_BR + N_OUT) : (N_UP + N_DN);
    LAS float* scr = (LAS float*)(lds + wave * 16384);
    if (gw >= NITEMS) return;
    TrItem cur = tr_decode<PART>(p, l, gw); v4f va[8], vb[8];
    tr_load(cur, lane, va);
    for (int it = gw; it < NITEMS; it += 2 * NGW) {
        const int i1 = it + NGW, i2 = it + 2 * NGW; TrItem nx = cur;
        if (i1 < NITEMS) { nx = tr_decode<PART>(p, l, i1); } tr_load(nx, lane, vb);
        tr_store(cur, va, scr, lane, nostore);
        if (i1 >= NITEMS) break;
        cur = nx; if (i2 < NITEMS) { cur = tr_decode<PART>(p, l, i2); } tr_load(cur, lane, va);
        tr_store(nx, vb, scr, lane, nostore);
        if (i2 >= NITEMS) break;
    }
}
__device__ __forceinline__ void phase_xprep(const Params& p, int l, const void* xin, bool xbf, LAS unsigned char* lds, int gw, int NGW, int tid, int lane) {
    const float* w_in = p.in[I_WIN] + (size_t)l * D * INC;
    constexpr int XP = 2052; LAS float* xt = (LAS float*)lds; LAS float* part = (LAS float*)lds;
    const int wave = tid >> 6, n_l = lane & 15, kq = lane >> 4, wg = gw >> 3, G = NGW >> 3;
    const int colw = n_l < 8 ? 4608 + n_l : 6152 + (n_l - 8);
    float bw[64];
#pragma unroll
    for (int q = 0; q < 64; ++q) bw[q] = w_in[(size_t)(256 * wave + 16 * (q >> 2) + 4 * kq + (q & 3)) * INC + colw];
    unsigned char* XB = p.ws + WS_XB; float* SMALL = (float*)(p.ws + WS_SMALL);
    __syncthreads();
    for (int tg = wg; tg < T / 16; tg += G) {
        {   v4f va[8], vb[8]; const size_t m0 = (size_t)tg * 16 + 2 * wave;
#pragma unroll
            for (int j = 0; j < 8; ++j) { va[j] = ld4(xin, m0 * D + 4 * lane + 256 * j, xbf); vb[j] = ld4(xin, (m0 + 1) * D + 4 * lane + 256 * j, xbf); }
#pragma unroll
            for (int rr = 0; rr < 2; ++rr) { unsigned* xo = (unsigned*)(XB + (m0 + rr) * D) + lane;
#pragma unroll
                for (int j = 0; j < 8; ++j) { const v4f v = rr ? vb[j] : va[j]; unsigned w = 0; w = __builtin_amdgcn_cvt_pk_fp8_f32(v.x, v.y, w, false); w = __builtin_amdgcn_cvt_pk_fp8_f32(v.z, v.w, w, true); xo[64 * j] = w;
                    *(LAS v4f*)(xt + (2 * wave + rr) * XP + 4 * lane + 256 * j) = v; } } }
        __syncthreads();
        {   pg8::f32x4 acc[4];
#pragma unroll
            for (int i = 0; i < 4; ++i) acc[i] = (pg8::f32x4){0.f, 0.f, 0.f, 0.f};
            const LAS float* xa = xt + n_l * XP + 256 * wave + 4 * kq;
#pragma unroll
            for (int s2 = 0; s2 < 16; ++s2) { const v4f a4 = *(const LAS v4f*)(xa + 16 * s2);
                acc[0] = __builtin_amdgcn_mfma_f32_16x16x4f32(a4.x, bw[4 * s2 + 0], acc[0], 0, 0, 0); acc[1] = __builtin_amdgcn_mfma_f32_16x16x4f32(a4.y, bw[4 * s2 + 1], acc[1], 0, 0, 0);
                acc[2] = __builtin_amdgcn_mfma_f32_16x16x4f32(a4.z, bw[4 * s2 + 2], acc[2], 0, 0, 0); acc[3] = __builtin_amdgcn_mfma_f32_16x16x4f32(a4.w, bw[4 * s2 + 3], acc[3], 0, 0, 0); }
            const pg8::f32x4 tot = (acc[0] + acc[1]) + (acc[2] + acc[3]);
            __syncthreads();
#pragma unroll
            for (int j = 0; j < 4; ++j) part[(wave * 16 + 4 * kq + j) * 16 + n_l] = tot[j]; }
        __syncthreads();
        if (tid < 256) { float a = 0.f;
#pragma unroll
            for (int w = 0; w < 8; ++w) a += part[w * 256 + tid];
            SMALL[(size_t)tg * 256 + tid] = a; }
        __syncthreads();
    }
}


typedef short bf16x8_t __attribute__((ext_vector_type(8)));
__device__ __forceinline__ void ml_pre_item(const Params& p, int l, LAS unsigned char* lds, int item, int tid, int wave, int lane) {
    const int h = item & 3, n = item >> 2; const size_t t0 = (size_t)n * 64;
    const bf16* Z = (const bf16*)(p.ws + WS_Z); const float* SMALL = (const float*)(p.ws + WS_SMALL);
    bf16* MQ = (bf16*)(p.ws + WS_MQ) + (size_t)item * 4096; bf16* MS = (bf16*)(p.ws + WS_MS) + (size_t)item * 4096; bf16* MK = (bf16*)(p.ws + WS_MK) + (size_t)item * 4096;
    bf16* MV = (bf16*)(p.ws + WS_MV) + (size_t)item * 9216; float* MFL = (float*)(p.ws + WS_MFL);
    LAS float* qs = (LAS float*)lds;
    LAS float* ks = qs + 64 * 65;
    LAS float* bs = ks + 64 * 65;
    LAS unsigned short* vs = (LAS unsigned short*)(bs + 128);
    { const int tk = tid >> 3, c8 = tid & 7; float f[8];
      unpack8(*(const v4u*)(Z + (t0 + tk) * ZC + ZC_MLQ + h * 64 + 8 * c8), f);
#pragma unroll
      for (int i = 0; i < 8; ++i) qs[tk * 65 + 8 * c8 + i] = f[i];
      unpack8(*(const v4u*)(Z + (t0 + tk) * ZC + ZC_MLK + h * 64 + 8 * c8), f);
#pragma unroll
      for (int i = 0; i < 8; ++i) ks[tk * 65 + 8 * c8 + i] = f[i]; }
#pragma unroll
    for (int r = 0; r < 2; ++r) { const int idx = tid + 512 * r, tk = idx >> 4, c8 = idx & 15;
        *(LAS v4u*)(vs + tk * 136 + 8 * c8) = *(const v4u*)(Z + (t0 + tk) * ZC + ZC_MLV + h * 128 + 8 * c8); }
    if (wave == 0) { const float fp = SMALL[(t0 + lane) * 16 + 12 + h] + p.in[I_MLFB][l * 4 + h]; const float lf = -softplusf_(-fp);
        bs[lane] = wave_scan_incl(lf); bs[64 + lane] = SMALL[(t0 + lane) * 16 + 8 + h] + p.in[I_MLIB][l * 4 + h]; }
    __syncthreads();
    const float blast = bs[63];
    { const int i = tid >> 3, jb = tid & 7; const float bi = bs[i];
      { const float e = __expf(bi) * 0.125f; float o[8];
#pragma unroll
        for (int x = 0; x < 8; ++x) o[x] = qs[i * 65 + 8 * jb + x] * e;
        v4u w; w.x = pk2(o[0], o[1]); w.y = pk2(o[2], o[3]); w.z = pk2(o[4], o[5]); w.w = pk2(o[6], o[7]); *(v4u*)(MQ + i * 64 + 8 * jb) = w; }
      { float d[8];
#pragma unroll
        for (int x = 0; x < 8; ++x) d[x] = 0.f;
        if (8 * jb <= i) {
            for (int dd = 0; dd < 64; ++dd) { const float qv = qs[i * 65 + dd];
#pragma unroll
                for (int x = 0; x < 8; ++x) d[x] += qv * ks[(8 * jb + x) * 65 + dd]; }
#pragma unroll
            for (int x = 0; x < 8; ++x) { const int j = 8 * jb + x; d[x] = (j <= i) ? __expf(bi - bs[j] + bs[64 + j]) * d[x] * 0.125f : 0.f; } }
        v4u w; w.x = pk2(d[0], d[1]); w.y = pk2(d[2], d[3]); w.z = pk2(d[4], d[5]); w.w = pk2(d[6], d[7]); *(v4u*)(MS + i * 64 + 8 * jb) = w; }
      { float o[8];
#pragma unroll
        for (int x = 0; x < 8; ++x) { const int j = 8 * jb + x; o[x] = ks[j * 65 + i] * __expf(blast - bs[j] + bs[64 + j]); }
        v4u w; w.x = pk2(o[0], o[1]); w.y = pk2(o[2], o[3]); w.z = pk2(o[4], o[5]); w.w = pk2(o[6], o[7]); *(v4u*)(MK + i * 64 + 8 * jb) = w; }
    }
    { const int c = tid >> 2, jq = tid & 3; unsigned w[8];
#pragma unroll
      for (int x = 0; x < 8; ++x) w[x] = (unsigned)vs[(16 * jq + 2 * x) * 136 + c] | ((unsigned)vs[(16 * jq + 2 * x + 1) * 136 + c] << 16);
      *(v4u*)(MV + c * 64 + 16 * jq) = (v4u){w[0], w[1], w[2], w[3]}; *(v4u*)(MV + c * 64 + 16 * jq + 8) = (v4u){w[4], w[5], w[6], w[7]};
      if (tid < 64) { const int c2 = 128 + (tid >> 2); const unsigned one = (c2 == 128) ? 0x3F803F80u : 0u;
          *(v4u*)(MV + c2 * 64 + 16 * jq) = (v4u){one, one, one, one}; *(v4u*)(MV + c2 * 64 + 16 * jq + 8) = (v4u){one, one, one, one}; } }
    if (tid == 0) MFL[item] = __expf(blast);
    __syncthreads();
}
struct MlFrags { bf16x8_t q[2], s[2], kt[2], vt[2]; float fl; };
__device__ __forceinline__ void ml_load(MlFrags& F, const Params& p, int item, int offA, int offV) {
    const bf16* MQ = (const bf16*)(p.ws + WS_MQ) + (size_t)item * 4096; const bf16* MS = (const bf16*)(p.ws + WS_MS) + (size_t)item * 4096; const bf16* MK = (const bf16*)(p.ws + WS_MK) + (size_t)item * 4096;
    const bf16* MV = (const bf16*)(p.ws + WS_MV) + (size_t)item * 9216;
#pragma unroll
    for (int ks = 0; ks < 2; ++ks) { F.q[ks] = *(const bf16x8_t*)(MQ + offA + 32 * ks); F.s[ks] = *(const bf16x8_t*)(MS + offA + 32 * ks); F.kt[ks] = *(const bf16x8_t*)(MK + offA + 32 * ks); F.vt[ks] = *(const bf16x8_t*)(MV + offV + 32 * ks); }
    F.fl = ((const float*)(p.ws + WS_MFL))[item];
}
__device__ __forceinline__ void ml_seq(const Params& p, LAS unsigned char* lds, int wgi, int wave, int lane) {
    const int u = wgi * 2 + (wave >> 2), wi = wave & 3, h = u / 9, sl = u % 9, g = lane >> 4, c = lane & 15;
    LAS unsigned short* CT = (LAS unsigned short*)(lds + (wave >> 2) * 4096);
    float* HO = (float*)(p.ws + WS_HO); float* HDEN = (float*)(p.ws + WS_HDEN);
    const int offA = (16 * wi + c) * 64 + 8 * g, offV = (16 * sl + c) * 64 + 8 * g;
    *(LAS v2u*)(CT + c * 64 + 16 * wi + 4 * g) = (v2u){0u, 0u};
    pg8::f32x4 Cacc = {0.f, 0.f, 0.f, 0.f};
    __syncthreads();
    MlFrags F0, F1;
    ml_load(F0, p, h, offA, offV);
#define ML_STEP(F, n_) do { const int cur = (n_) & 1; \
        const bf16x8_t c0 = *(const LAS bf16x8_t*)(CT + cur * 1024 + c * 64 + 8 * g), c1 = *(const LAS bf16x8_t*)(CT + cur * 1024 + c * 64 + 32 + 8 * g); \
        pg8::f32x4 num = {0.f, 0.f, 0.f, 0.f}; \
        num = __builtin_amdgcn_mfma_f32_16x16x32_bf16(F.q[0], c0, num, 0, 0, 0); num = __builtin_amdgcn_mfma_f32_16x16x32_bf16(F.q[1], c1, num, 0, 0, 0); \
        num = __builtin_amdgcn_mfma_f32_16x16x32_bf16(F.s[0], F.vt[0], num, 0, 0, 0); num = __builtin_amdgcn_mfma_f32_16x16x32_bf16(F.s[1], F.vt[1], num, 0, 0, 0); \
        Cacc = Cacc * F.fl; \
        Cacc = __builtin_amdgcn_mfma_f32_16x16x32_bf16(F.kt[0], F.vt[0], Cacc, 0, 0, 0); Cacc = __builtin_amdgcn_mfma_f32_16x16x32_bf16(F.kt[1], F.vt[1], Cacc, 0, 0, 0); \
        { v2u w; w.x = pk2(Cacc[0], Cacc[1]); w.y = pk2(Cacc[2], Cacc[3]); *(LAS v2u*)(CT + (cur ^ 1) * 1024 + c * 64 + 16 * wi + 4 * g) = w; } \
        { const size_t tb = (size_t)(n_) * 64 + 16 * wi + 4 * g; \
          if (sl < 8) { _Pragma("unroll") for (int r = 0; r < 4; ++r) HO[(tb + r) * BW + h * 128 + 16 * sl + c] = num[r]; } \
          else if (c == 0) { _Pragma("unroll") for (int r = 0; r < 4; ++r) HDEN[(tb + r) * 4 + h] = num[r]; } } \
        LDS_BAR(); } while (0)
    for (int n = 0; n < T / 64; n += 2) {
        ml_load(F1, p, (n + 1) * 4 + h, offA, offV);
        ML_STEP(F0, n);
        ml_load(F0, p, ((n + 2 < T / 64) ? n + 2 : n) * 4 + h, offA, offV);
        ML_STEP(F1, n + 1);
    }
#undef ML_STEP
}


constexpr int QP = 132;
__device__ __forceinline__ void gdn_pre_item(const Params& p, int l, LAS unsigned char* lds, int item, int tid, int wave, int lane) {
    const int h = item & 3, n = item >> 2; const size_t t0 = (size_t)n * 64;
    const bf16* Z = (const bf16*)(p.ws + WS_Z); const float* SMALL = (const float*)(p.ws + WS_SMALL);
    float* GU = (float*)(p.ws + WS_GU) + (size_t)item * 8192; bf16* GNW = (bf16*)(p.ws + WS_GNW) + (size_t)item * 8192; bf16* GQG = (bf16*)(p.ws + WS_GQG) + (size_t)item * 8192;
    bf16* GAT = (bf16*)(p.ws + WS_GAT) + (size_t)item * 4096; bf16* GKT = (bf16*)(p.ws + WS_GKT) + (size_t)item * 8192; float* GDL = (float*)(p.ws + WS_GDL);
    const float* cw = p.in[I_CONVW] + (size_t)l * 4 * 1536;
    LAS float* qs = (LAS float*)lds; LAS float* ks = qs + 64 * QP; LAS float* vs = ks + 64 * QP; LAS float* Ls = vs + 64 * QP;   LAS float* gcs = Ls + 64 * 68; LAS float* bts = gcs + 64; LAS float* btg = bts + 64;
    { const int tk = tid >> 3, part = tid & 7;
#pragma unroll 1
      for (int i = 0; i < 3; ++i) { float a[16];
#pragma unroll
        for (int x = 0; x < 16; ++x) a[x] = 0.f;
#pragma unroll
        for (int j = 0; j < 4; ++j) { const long tt = (long)t0 + tk - 3 + j; if (tt >= 0) {
            const bf16* src = Z + (size_t)tt * ZC + ZC_GDN + i * 512 + h * 128 + 16 * part; float x0[8], x1[8]; unpack8(*(const v4u*)src, x0); unpack8(*(const v4u*)(src + 8), x1);
            const float* wp = cw + j * 1536 + i * 512 + h * 128 + 16 * part;
#pragma unroll
            for (int x = 0; x < 8; ++x) { a[x] += wp[x] * x0[x]; a[8 + x] += wp[8 + x] * x1[x]; } } }
        float ss = 0.f;
#pragma unroll
        for (int x = 0; x < 16; ++x) { a[x] = siluf_(a[x]); ss += a[x] * a[x]; }
        if (i < 2) { ss = sum8(ss); const float r = rsqrtf(ss + 1e-6f) * (i == 0 ? 0.08838834764831845f : 1.f);
#pragma unroll
            for (int x = 0; x < 16; ++x) a[x] *= r; }
        LAS float* dst = (i == 0 ? qs : (i == 1 ? ks : vs)) + tk * QP + 16 * part;
#pragma unroll
        for (int x4 = 0; x4 < 4; ++x4) *(LAS v4f*)(dst + 4 * x4) = (v4f){a[4 * x4], a[4 * x4 + 1], a[4 * x4 + 2], a[4 * x4 + 3]}; } }
    if (wave == 0) { const float bb = SMALL[(t0 + lane) * 16 + h], aa = SMALL[(t0 + lane) * 16 + 4 + h];
        const float g = -__expf(p.in[I_ALOG][l * 4 + h]) * softplusf_(aa + p.in[I_DTB][l * 4 + h]);
        const float gc = wave_scan_incl(g), bt = sigmoidf_(bb); gcs[lane] = gc; bts[lane] = bt; btg[lane] = bt * __expf(gc); }
    __syncthreads();
    { const int i = tid >> 3, jb = tid & 7; const float gi = gcs[i], bi = bts[i]; float dk[8], dq[8];
#pragma unroll
      for (int x = 0; x < 8; ++x) { dk[x] = 0.f; dq[x] = 0.f; }
      if (8 * jb <= i) {
#pragma unroll 2
          for (int d4 = 0; d4 < 32; ++d4) { const v4f qi = *(const LAS v4f*)(qs + i * QP + 4 * d4), ki = *(const LAS v4f*)(ks + i * QP + 4 * d4);
#pragma unroll
              for (int x = 0; x < 8; ++x) { const v4f kj = *(const LAS v4f*)(ks + (8 * jb + x) * QP + 4 * d4);
                  dk[x] += ki.x * kj.x + ki.y * kj.y + ki.z * kj.z + ki.w * kj.w; dq[x] += qi.x * kj.x + qi.y * kj.y + qi.z * kj.z + qi.w * kj.w; } }
#pragma unroll
          for (int x = 0; x < 8; ++x) { const int j = 8 * jb + x; const float dc = __expf(gi - gcs[j]); dk[x] = (j < i) ? bi * dk[x] * dc : 0.f; dq[x] = (j <= i) ? dq[x] * dc : 0.f; } }
      *(LAS v4f*)(Ls + i * 68 + 8 * jb) = (v4f){dk[0], dk[1], dk[2], dk[3]}; *(LAS v4f*)(Ls + i * 68 + 8 * jb + 4) = (v4f){dk[4], dk[5], dk[6], dk[7]};
      v4u w; w.x = pk2(dq[0], dq[1]); w.y = pk2(dq[2], dq[3]); w.z = pk2(dq[4], dq[5]); w.w = pk2(dq[6], dq[7]); *(v4u*)(GAT + i * 64 + 8 * jb) = w; }
    __syncthreads();
    if (tid < 256) {
        const int c = tid; int vz; asm volatile("v_mov_b32 %0, 0" : "=v"(vz));
        const LAS float* rp = (c < 128) ? (vs + c) : (ks + (c - 128)); const LAS float* mp = ((c < 128) ? bts : btg) + vz;
#define GDN_RHS(i) (rp[(i) * QP] * mp[(i)])
#define GDN_L4(i, j4) (*(const LAS v4f*)(Ls + (i) * 68 + 4 * (j4) + vz))
        float x0 = GDN_RHS(0); __builtin_amdgcn_sched_barrier(0);
        float x1 = GDN_RHS(1); { const v4f l = GDN_L4(1, 0); x1 -= l.x * x0; } __builtin_amdgcn_sched_barrier(0);
        float x2 = GDN_RHS(2); { const v4f l = GDN_L4(2, 0); x2 -= l.x * x0; x2 -= l.y * x1; } __builtin_amdgcn_sched_barrier(0);
        float x3 = GDN_RHS(3); { const v4f l = GDN_L4(3, 0); x3 -= l.x * x0; x3 -= l.y * x1; x3 -= l.z * x2; } __builtin_amdgcn_sched_barrier(0);
        float x4 = GDN_RHS(4); { const v4f l = GDN_L4(4, 0); x4 -= l.x * x0; x4 -= l.y * x1; x4 -= l.z * x2; x4 -= l.w * x3; } __builtin_amdgcn_sched_barrier(0);
        float x5 = GDN_RHS(5); { const v4f l = GDN_L4(5, 0); x5 -= l.x * x0; x5 -= l.y * x1; x5 -= l.z * x2; x5 -= l.w * x3; } { const v4f l = GDN_L4(5, 1); x5 -= l.x * x4; } __builtin_amdgcn_sched_barrier(0);
        float x6 = GDN_RHS(6); { const v4f l = GDN_L4(6, 0); x6 -= l.x * x0; x6 -= l.y * x1; x6 -= l.z * x2; x6 -= l.w * x3; } { const v4f l = GDN_L4(6, 1); x6 -= l.x * x4; x6 -= l.y * x5; } __builtin_amdgcn_sched_barrier(0);
        float x7 = GDN_RHS(7); { const v4f l = GDN_L4(7, 0); x7 -= l.x * x0; x7 -= l.y * x1; x7 -= l.z * x2; x7 -= l.w * x3; } { const v4f l = GDN_L4(7, 1); x7 -= l.x * x4; x7 -= l.y * x5; x7 -= l.z * x6; } __builtin_amdgcn_sched_barrier(0);
        float x8 = GDN_RHS(8); { const v4f l = GDN_L4(8, 0); x8 -= l.x * x0; x8 -= l.y * x1; x8 -= l.z * x2; x8 -= l.w * x3; } { const v4f l = GDN_L4(8, 1); x8 -= l.x * x4; x8 -= l.y * x5; x8 -= l.z * x6; x8 -= l.w * x7; } __builtin_amdgcn_sched_barrier(0);
        float x9 = GDN_RHS(9); { const v4f l = GDN_L4(9, 0); x9 -= l.x * x0; x9 -= l.y * x1; x9 -= l.z * x2; x9 -= l.w * x3; } { const v4f l = GDN_L4(9, 1); x9 -= l.x * x4; x9 -= l.y * x5; x9 -= l.z * x6; x9 -= l.w * x7; } { const v4f l = GDN_L4(9, 2); x9 -= l.x * x8; } __builtin_amdgcn_sched_barrier(0);
        float x10 = GDN_RHS(10); { const v4f l = GDN_L4(10, 0); x10 -= l.x * x0; x10 -= l.y * x1; x10 -= l.z * x2; x10 -= l.w * x3; } { const v4f l = GDN_L4(10, 1); x10 -= l.x * x4; x10 -= l.y * x5; x10 -= l.z * x6; x10 -= l.w * x7; } { const v4f l = GDN_L4(10, 2); x10 -= l.x * x8; x10 -= l.y * x9; } __builtin_amdgcn_sched_barrier(0);
        float x11 = GDN_RHS(11); { const v4f l = GDN_L4(11, 0); x11 -= l.x * x0; x11 -= l.y * x1; x11 -= l.z * x2; x11 -= l.w * x3; } { const v4f l = GDN_L4(11, 1); x11 -= l.x * x4; x11 -= l.y * x5; x11 -= l.z * x6; x11 -= l.w * x7; } { const v4f l = GDN_L4(11, 2); x11 -= l.x * x8; x11 -= l.y * x9; x11 -= l.z * x10; } __builtin_amdgcn_sched_barrier(0);
        float x12 = GDN_RHS(12); { const v4f l = GDN_L4(12, 0); x12 -= l.x * x0; x12 -= l.y * x1; x12 -= l.z * x2; x12 -= l.w * x3; } { const v4f l = GDN_L4(12, 1); x12 -= l.x * x4; x12 -= l.y * x5; x12 -= l.z * x6; x12 -= l.w * x7; } { const v4f l = GDN_L4(12, 2); x12 -= l.x * x8; x12 -= l.y * x9; x12 -= l.z * x10; x12 -= l.w * x11; } __builtin_amdgcn_sched_barrier(0);
        float x13 = GDN_RHS(13); { const v4f l = GDN_L4(13, 0); x13 -= l.x * x0; x13 -= l.y * x1; x13 -= l.z * x2; x13 -= l.w * x3; } { const v4f l = GDN_L4(13, 1); x13 -= l.x * x4; x13 -= l.y * x5; x13 -= l.z * x6; x13 -= l.w * x7; } { const v4f l = GDN_L4(13, 2); x13 -= l.x * x8; x13 -= l.y * x9; x13 -= l.z * x10; x13 -= l.w * x11; } { const v4f l = GDN_L4(13, 3); x13 -= l.x * x12; } __builtin_amdgcn_sched_barrier(0);
        float x14 = GDN_RHS(14); { const v4f l = GDN_L4(14, 0); x14 -= l.x * x0; x14 -= l.y * x1; x14 -= l.z * x2; x14 -= l.w * x3; } { const v4f l = GDN_L4(14, 1); x14 -= l.x * x4; x14 -= l.y * x5; x14 -= l.z * x6; x14 -= l.w * x7; } { const v4f l = GDN_L4(14, 2); x14 -= l.x * x8; x14 -= l.y * x9; x14 -= l.z * x10; x14 -= l.w * x11; } { const v4f l = GDN_L4(14, 3); x14 -= l.x * x12; x14 -= l.y * x13; } __builtin_amdgcn_sched_barrier(0);
        float x15 = GDN_RHS(15); { const v4f l = GDN_L4(15, 0); x15 -= l.x * x0; x15 -= l.y * x1; x15 -= l.z * x2; x15 -= l.w * x3; } { const v4f l = GDN_L4(15, 1); x15 -= l.x * x4; x15 -= l.y * x5; x15 -= l.z * x6; x15 -= l.w * x7; } { const v4f l = GDN_L4(15, 2); x15 -= l.x * x8; x15 -= l.y * x9; x15 -= l.z * x10; x15 -= l.w * x11; } { const v4f l = GDN_L4(15, 3); x15 -= l.x * x12; x15 -= l.y * x13; x15 -= l.z * x14; } __builtin_amdgcn_sched_barrier(0);
        float x16 = GDN_RHS(16); { const v4f l = GDN_L4(16, 0); x16 -= l.x * x0; x16 -= l.y * x1; x16 -= l.z * x2; x16 -= l.w * x3; } { const v4f l = GDN_L4(16, 1); x16 -= l.x * x4; x16 -= l.y * x5; x16 -= l.z * x6; x16 -= l.w * x7; } { const v4f l = GDN_L4(16, 2); x16 -= l.x * x8; x16 -= l.y * x9; x16 -= l.z * x10; x16 -= l.w * x11; } { const v4f l = GDN_L4(16, 3); x16 -= l.x * x12; x16 -= l.y * x13; x16 -= l.z * x14; x16 -= l.w * x15; } __builtin_amdgcn_sched_barrier(0);
        float x17 = GDN_RHS(17); { const v4f l = GDN_L4(17, 0); x17 -= l.x * x0; x17 -= l.y * x1; x17 -= l.z * x2; x17 -= l.w * x3; } { const v4f l = GDN_L4(17, 1); x17 -= l.x * x4; x17 -= l.y * x5; x17 -= l.z * x6; x17 -= l.w * x7; } { const v4f l = GDN_L4(17, 2); x17 -= l.x * x8; x17 -= l.y * x9; x17 -= l.z * x10; x17 -= l.w * x11; } { const v4f l = GDN_L4(17, 3); x17 -= l.x * x12; x17 -= l.y * x13; x17 -= l.z * x14; x17 -= l.w * x15; } { const v4f l = GDN_L4(17, 4); x17 -= l.x * x16; } __builtin_amdgcn_sched_barrier(0);
        float x18 = GDN_RHS(18); { const v4f l = GDN_L4(18, 0); x18 -= l.x * x0; x18 -= l.y * x1; x18 -= l.z * x2; x18 -= l.w * x3; } { const v4f l = GDN_L4(18, 1); x18 -= l.x * x4; x18 -= l.y * x5; x18 -= l.z * x6; x18 -= l.w * x7; } { const v4f l = GDN_L4(18, 2); x18 -= l.x * x8; x18 -= l.y * x9; x18 -= l.z * x10; x18 -= l.w * x11; } { const v4f l = GDN_L4(18, 3); x18 -= l.x * x12; x18 -= l.y * x13; x18 -= l.z * x14; x18 -= l.w * x15; } { const v4f l = GDN_L4(18, 4); x18 -= l.x * x16; x18 -= l.y * x17; } __builtin_amdgcn_sched_barrier(0);
        float x19 = GDN_RHS(19); { const v4f l = GDN_L4(19, 0); x19 -= l.x * x0; x19 -= l.y * x1; x19 -= l.z * x2; x19 -= l.w * x3; } { const v4f l = GDN_L4(19, 1); x19 -= l.x * x4; x19 -= l.y * x5; x19 -= l.z * x6; x19 -= l.w * x7; } { const v4f l = GDN_L4(19, 2); x19 -= l.x * x8; x19 -= l.y * x9; x19 -= l.z * x10; x19 -= l.w * x11; } { const v4f l = GDN_L4(19, 3); x19 -= l.x * x12; x19 -= l.y * x13; x19 -= l.z * x14; x19 -= l.w * x15; } { const v4f l = GDN_L4(19, 4); x19 -= l.x * x16; x19 -= l.y * x17; x19 -= l.z * x18; } __builtin_amdgcn_sched_barrier(0);
        float x20 = GDN_RHS(20); { const v4f l = GDN_L4(20, 0); x20 -= l.x * x0; x20 -= l.y * x1; x20 -= l.z * x2; x20 -= l.w * x3; } { const v4f l = GDN_L4(20, 1); x20 -= l.x * x4; x20 -= l.y * x5; x20 -= l.z * x6; x20 -= l.w * x7; } { const v4f l = GDN_L4(20, 2); x20 -= l.x * x8; x20 -= l.y * x9; x20 -= l.z * x10; x20 -= l.w * x11; } { const v4f l = GDN_L4(20, 3); x20 -= l.x * x12; x20 -= l.y * x13; x20 -= l.z * x14; x20 -= l.w * x15; } { const v4f l = GDN_L4(20, 4); x20 -= l.x * x16; x20 -= l.y * x17; x20 -= l.z * x18; x20 -= l.w * x19; } __builtin_amdgcn_sched_barrier(0);
        float x21 = GDN_RHS(21); { const v4f l = GDN_L4(21, 0); x21 -= l.x * x0; x21 -= l.y * x1; x21 -= l.z * x2; x21 -= l.w * x3; } { const v4f l = GDN_L4(21, 1); x21 -= l.x * x4; x21 -= l.y * x5; x21 -= l.z * x6; x21 -= l.w * x7; } { const v4f l = GDN_L4(21, 2); x21 -= l.x * x8; x21 -= l.y * x9; x21 -= l.z * x10; x21 -= l.w * x11; } { const v4f l = GDN_L4(21, 3); x21 -= l.x * x12; x21 -= l.y * x13; x21 -= l.z * x14; x21 -= l.w * x15; } { const v4f l = GDN_L4(21, 4); x21 -= l.x * x16; x21 -= l.y * x17; x21 -= l.z * x18; x21 -= l.w * x19; } { const v4f l = GDN_L4(21, 5); x21 -= l.x * x20; } __builtin_amdgcn_sched_barrier(0);
        float x22 = GDN_RHS(22); { const v4f l = GDN_L4(22, 0); x22 -= l.x * x0; x22 -= l.y * x1; x22 -= l.z * x2; x22 -= l.w * x3; } { const v4f l = GDN_L4(22, 1); x22 -= l.x * x4; x22 -= l.y * x5; x22 -= l.z * x6; x22 -= l.w * x7; } { const v4f l = GDN_L4(22, 2); x22 -= l.x * x8; x22 -= l.y * x9; x22 -= l.z * x10; x22 -= l.w * x11; } { const v4f l = GDN_L4(22, 3); x22 -= l.x * x12; x22 -= l.y * x13; x22 -= l.z * x14; x22 -= l.w * x15; } { const v4f l = GDN_L4(22, 4); x22 -= l.x * x16; x22 -= l.y * x17; x22 -= l.z * x18; x22 -= l.w * x19; } { const v4f l = GDN_L4(22, 5); x22 -= l.x * x20; x22 -= l.y * x21; } __builtin_amdgcn_sched_barrier(0);
        float x23 = GDN_RHS(23); { const v4f l = GDN_L4(23, 0); x23 -= l.x * x0; x23 -= l.y * x1; x23 -= l.z * x2; x23 -= l.w * x3; } { const v4f l = GDN_L4(23, 1); x23 -= l.x * x4; x23 -= l.y * x5; x23 -= l.z * x6; x23 -= l.w * x7; } { const v4f l = GDN_L4(23, 2); x23 -= l.x * x8; x23 -= l.y * x9; x23 -= l.z * x10; x23 -= l.w * x11; } { const v4f l = GDN_L4(23, 3); x23 -= l.x * x12; x23 -= l.y * x13; x23 -= l.z * x14; x23 -= l.w * x15; } { const v4f l = GDN_L4(23, 4); x23 -= l.x * x16; x23 -= l.y * x17; x23 -= l.z * x18; x23 -= l.w * x19; } { const v4f l = GDN_L4(23, 5); x23 -= l.x * x20; x23 -= l.y * x21; x23 -= l.z * x22; } __builtin_amdgcn_sched_barrier(0);
        float x24 = GDN_RHS(24); { const v4f l = GDN_L4(24, 0); x24 -= l.x * x0; x24 -= l.y * x1; x24 -= l.z * x2; x24 -= l.w * x3; } { const v4f l = GDN_L4(24, 1); x24 -= l.x * x4; x24 -= l.y * x5; x24 -= l.z * x6; x24 -= l.w * x7; } { const v4f l = GDN_L4(24, 2); x24 -= l.x * x8; x24 -= l.y * x9; x24 -= l.z * x10; x24 -= l.w * x11; } { const v4f l = GDN_L4(24, 3); x24 -= l.x * x12; x24 -= l.y * x13; x24 -= l.z * x14; x24 -= l.w * x15; } { const v4f l = GDN_L4(24, 4); x24 -= l.x * x16; x24 -= l.y * x17; x24 -= l.z * x18; x24 -= l.w * x19; } { const v4f l = GDN_L4(24, 5); x24 -= l.x * x20; x24 -= l.y * x21; x24 -= l.z * x22; x24 -= l.w * x23; } __builtin_amdgcn_sched_barrier(0);
        float x25 = GDN_RHS(25); { const v4f l = GDN_L4(25, 0); x25 -= l.x * x0; x25 -= l.y * x1; x25 -= l.z * x2; x25 -= l.w * x3; } { const v4f l = GDN_L4(25, 1); x25 -= l.x * x4; x25 -= l.y * x5; x25 -= l.z * x6; x25 -= l.w * x7; } { const v4f l = GDN_L4(25, 2); x25 -= l.x * x8; x25 -= l.y * x9; x25 -= l.z * x10; x25 -= l.w * x11; } { const v4f l = GDN_L4(25, 3); x25 -= l.x * x12; x25 -= l.y * x13; x25 -= l.z * x14; x25 -= l.w * x15; } { const v4f l = GDN_L4(25, 4); x25 -= l.x * x16; x25 -= l.y * x17; x25 -= l.z * x18; x25 -= l.w * x19; } { const v4f l = GDN_L4(25, 5); x25 -= l.x * x20; x25 -= l.y * x21; x25 -= l.z * x22; x25 -= l.w * x23; } { const v4f l = GDN_L4(25, 6); x25 -= l.x * x24; } __builtin_amdgcn_sched_barrier(0);
        float x26 = GDN_RHS(26); { const v4f l = GDN_L4(26, 0); x26 -= l.x * x0; x26 -= l.y * x1; x26 -= l.z * x2; x26 -= l.w * x3; } { const v4f l = GDN_L4(26, 1); x26 -= l.x * x4; x26 -= l.y * x5; x26 -= l.z * x6; x26 -= l.w * x7; } { const v4f l = GDN_L4(26, 2); x26 -= l.x * x8; x26 -= l.y * x9; x26 -= l.z * x10; x26 -= l.w * x11; } { const v4f l = GDN_L4(26, 3); x26 -= l.x * x12; x26 -= l.y * x13; x26 -= l.z * x14; x26 -= l.w * x15; } { const v4f l = GDN_L4(26, 4); x26 -= l.x * x16; x26 -= l.y * x17; x26 -= l.z * x18; x26 -= l.w * x19; } { const v4f l = GDN_L4(26, 5); x26 -= l.x * x20; x26 -= l.y * x21; x26 -= l.z * x22; x26 -= l.w * x23; } { const v4f l = GDN_L4(26, 6); x26 -= l.x * x24; x26 -= l.y * x25; } __builtin_amdgcn_sched_barrier(0);
        float x27 = GDN_RHS(27); { const v4f l = GDN_L4(27, 0); x27 -= l.x * x0; x27 -= l.y * x1; x27 -= l.z * x2; x27 -= l.w * x3; } { const v4f l = GDN_L4(27, 1); x27 -= l.x * x4; x27 -= l.y * x5; x27 -= l.z * x6; x27 -= l.w * x7; } { const v4f l = GDN_L4(27, 2); x27 -= l.x * x8; x27 -= l.y * x9; x27 -= l.z * x10; x27 -= l.w * x11; } { const v4f l = GDN_L4(27, 3); x27 -= l.x * x12; x27 -= l.y * x13; x27 -= l.z * x14; x27 -= l.w * x15; } { const v4f l = GDN_L4(27, 4); x27 -= l.x * x16; x27 -= l.y * x17; x27 -= l.z * x18; x27 -= l.w * x19; } { const v4f l = GDN_L4(27, 5); x27 -= l.x * x20; x27 -= l.y * x21; x27 -= l.z * x22; x27 -= l.w * x23; } { const v4f l = GDN_L4(27, 6); x27 -= l.x * x24; x27 -= l.y * x25; x27 -= l.z * x26; } __builtin_amdgcn_sched_barrier(0);
        float x28 = GDN_RHS(28); { const v4f l = GDN_L4(28, 0); x28 -= l.x * x0; x28 -= l.y * x1; x28 -= l.z * x2; x28 -= l.w * x3; } { const v4f l = GDN_L4(28, 1); x28 -= l.x * x4; x28 -= l.y * x5; x28 -= l.z * x6; x28 -= l.w * x7; } { const v4f l = GDN_L4(28, 2); x28 -= l.x * x8; x28 -= l.y * x9; x28 -= l.z * x10; x28 -= l.w * x11; } { const v4f l = GDN_L4(28, 3); x28 -= l.x * x12; x28 -= l.y * x13; x28 -= l.z * x14; x28 -= l.w * x15; } { const v4f l = GDN_L4(28, 4); x28 -= l.x * x16; x28 -= l.y * x17; x28 -= l.z * x18; x28 -= l.w * x19; } { const v4f l = GDN_L4(28, 5); x28 -= l.x * x20; x28 -= l.y * x21; x28 -= l.z * x22; x28 -= l.w * x23; } { const v4f l = GDN_L4(28, 6); x28 -= l.x * x24; x28 -= l.y * x25; x28 -= l.z * x26; x28 -= l.w * x27; } __builtin_amdgcn_sched_barrier(0);
        float x29 = GDN_RHS(29); { const v4f l = GDN_L4(29, 0); x29 -= l.x * x0; x29 -= l.y * x1; x29 -= l.z * x2; x29 -= l.w * x3; } { const v4f l = GDN_L4(29, 1); x29 -= l.x * x4; x29 -= l.y * x5; x29 -= l.z * x6; x29 -= l.w * x7; } { const v4f l = GDN_L4(29, 2); x29 -= l.x * x8; x29 -= l.y * x9; x29 -= l.z * x10; x29 -= l.w * x11; } { const v4f l = GDN_L4(29, 3); x29 -= l.x * x12; x29 -= l.y * x13; x29 -= l.z * x14; x29 -= l.w * x15; } { const v4f l = GDN_L4(29, 4); x29 -= l.x * x16; x29 -= l.y * x17; x29 -= l.z * x18; x29 -= l.w * x19; } { const v4f l = GDN_L4(29, 5); x29 -= l.x * x20; x29 -= l.y * x21; x29 -= l.z * x22; x29 -= l.w * x23; } { const v4f l = GDN_L4(29, 6); x29 -= l.x * x24; x29 -= l.y * x25; x29 -= l.z * x26; x29 -= l.w * x27; } { const v4f l = GDN_L4(29, 7); x29 -= l.x * x28; } __builtin_amdgcn_sched_barrier(0);
        float x30 = GDN_RHS(30); { const v4f l = GDN_L4(30, 0); x30 -= l.x * x0; x30 -= l.y * x1; x30 -= l.z * x2; x30 -= l.w * x3; } { const v4f l = GDN_L4(30, 1); x30 -= l.x * x4; x30 -= l.y * x5; x30 -= l.z * x6; x30 -= l.w * x7; } { const v4f l = GDN_L4(30, 2); x30 -= l.x * x8; x30 -= l.y * x9; x30 -= l.z * x10; x30 -= l.w * x11; } { const v4f l = GDN_L4(30, 3); x30 -= l.x * x12; x30 -= l.y * x13; x30 -= l.z * x14; x30 -= l.w * x15; } { const v4f l = GDN_L4(30, 4); x30 -= l.x * x16; x30 -= l.y * x17; x30 -= l.z * x18; x30 -= l.w * x19; } { const v4f l = GDN_L4(30, 5); x30 -= l.x * x20; x30 -= l.y * x21; x30 -= l.z * x22; x30 -= l.w * x23; } { const v4f l = GDN_L4(30, 6); x30 -= l.x * x24; x30 -= l.y * x25; x30 -= l.z * x26; x30 -= l.w * x27; } { const v4f l = GDN_L4(30, 7); x30 -= l.x * x28; x30 -= l.y * x29; } __builtin_amdgcn_sched_barrier(0);
        float x31 = GDN_RHS(31); { const v4f l = GDN_L4(31, 0); x31 -= l.x * x0; x31 -= l.y * x1; x31 -= l.z * x2; x31 -= l.w * x3; } { const v4f l = GDN_L4(31, 1); x31 -= l.x * x4; x31 -= l.y * x5; x31 -= l.z * x6; x31 -= l.w * x7; } { const v4f l = GDN_L4(31, 2); x31 -= l.x * x8; x31 -= l.y * x9; x31 -= l.z * x10; x31 -= l.w * x11; } { const v4f l = GDN_L4(31, 3); x31 -= l.x * x12; x31 -= l.y * x13; x31 -= l.z * x14; x31 -= l.w * x15; } { const v4f l = GDN_L4(31, 4); x31 -= l.x * x16; x31 -= l.y * x17; x31 -= l.z * x18; x31 -= l.w * x19; } { const v4f l = GDN_L4(31, 5); x31 -= l.x * x20; x31 -= l.y * x21; x31 -= l.z * x22; x31 -= l.w * x23; } { const v4f l = GDN_L4(31, 6); x31 -= l.x * x24; x31 -= l.y * x25; x31 -= l.z * x26; x31 -= l.w * x27; } { const v4f l = GDN_L4(31, 7); x31 -= l.x * x28; x31 -= l.y * x29; x31 -= l.z * x30; } __builtin_amdgcn_sched_barrier(0);
        float x32 = GDN_RHS(32); { const v4f l = GDN_L4(32, 0); x32 -= l.x * x0; x32 -= l.y * x1; x32 -= l.z * x2; x32 -= l.w * x3; } { const v4f l = GDN_L4(32, 1); x32 -= l.x * x4; x32 -= l.y * x5; x32 -= l.z * x6; x32 -= l.w * x7; } { const v4f l = GDN_L4(32, 2); x32 -= l.x * x8; x32 -= l.y * x9; x32 -= l.z * x10; x32 -= l.w * x11; } { const v4f l = GDN_L4(32, 3); x32 -= l.x * x12; x32 -= l.y * x13; x32 -= l.z * x14; x32 -= l.w * x15; } { const v4f l = GDN_L4(32, 4); x32 -= l.x * x16; x32 -= l.y * x17; x32 -= l.z * x18; x32 -= l.w * x19; } { const v4f l = GDN_L4(32, 5); x32 -= l.x * x20; x32 -= l.y * x21; x32 -= l.z * x22; x32 -= l.w * x23; } { const v4f l = GDN_L4(32, 6); x32 -= l.x * x24; x32 -= l.y * x25; x32 -= l.z * x26; x32 -= l.w * x27; } { const v4f l = GDN_L4(32, 7); x32 -= l.x * x28; x32 -= l.y * x29; x32 -= l.z * x30; x32 -= l.w * x31; } __builtin_amdgcn_sched_barrier(0);
        float x33 = GDN_RHS(33); { const v4f l = GDN_L4(33, 0); x33 -= l.x * x0; x33 -= l.y * x1; x33 -= l.z * x2; x33 -= l.w * x3; } { const v4f l = GDN_L4(33, 1); x33 -= l.x * x4; x33 -= l.y * x5; x33 -= l.z * x6; x33 -= l.w * x7; } { const v4f l = GDN_L4(33, 2); x33 -= l.x * x8; x33 -= l.y * x9; x33 -= l.z * x10; x33 -= l.w * x11; } { const v4f l = GDN_L4(33, 3); x33 -= l.x * x12; x33 -= l.y * x13; x33 -= l.z * x14; x33 -= l.w * x15; } { const v4f l = GDN_L4(33, 4); x33 -= l.x * x16; x33 -= l.y * x17; x33 -= l.z * x18; x33 -= l.w * x19; } { const v4f l = GDN_L4(33, 5); x33 -= l.x * x20; x33 -= l.y * x21; x33 -= l.z * x22; x33 -= l.w * x23; } { const v4f l = GDN_L4(33, 6); x33 -= l.x * x24; x33 -= l.y * x25; x33 -= l.z * x26; x33 -= l.w * x27; } { const v4f l = GDN_L4(33, 7); x33 -= l.x * x28; x33 -= l.y * x29; x33 -= l.z * x30; x33 -= l.w * x31; } { const v4f l = GDN_L4(33, 8); x33 -= l.x * x32; } __builtin_amdgcn_sched_barrier(0);
        float x34 = GDN_RHS(34); { const v4f l = GDN_L4(34, 0); x34 -= l.x * x0; x34 -= l.y * x1; x34 -= l.z * x2; x34 -= l.w * x3; } { const v4f l = GDN_L4(34, 1); x34 -= l.x * x4; x34 -= l.y * x5; x34 -= l.z * x6; x34 -= l.w * x7; } { const v4f l = GDN_L4(34, 2); x34 -= l.x * x8; x34 -= l.y * x9; x34 -= l.z * x10; x34 -= l.w * x11; } { const v4f l = GDN_L4(34, 3); x34 -= l.x * x12; x34 -= l.y * x13; x34 -= l.z * x14; x34 -= l.w * x15; } { const v4f l = GDN_L4(34, 4); x34 -= l.x * x16; x34 -= l.y * x17; x34 -= l.z * x18; x34 -= l.w * x19; } { const v4f l = GDN_L4(34, 5); x34 -= l.x * x20; x34 -= l.y * x21; x34 -= l.z * x22; x34 -= l.w * x23; } { const v4f l = GDN_L4(34, 6); x34 -= l.x * x24; x34 -= l.y * x25; x34 -= l.z * x26; x34 -= l.w * x27; } { const v4f l = GDN_L4(34, 7); x34 -= l.x * x28; x34 -= l.y * x29; x34 -= l.z * x30; x34 -= l.w * x31; } { const v4f l = GDN_L4(34, 8); x34 -= l.x * x32; x34 -= l.y * x33; } __builtin_amdgcn_sched_barrier(0);
        float x35 = GDN_RHS(35); { const v4f l = GDN_L4(35, 0); x35 -= l.x * x0; x35 -= l.y * x1; x35 -= l.z * x2; x35 -= l.w * x3; } { const v4f l = GDN_L4(35, 1); x35 -= l.x * x4; x35 -= l.y * x5; x35 -= l.z * x6; x35 -= l.w * x7; } { const v4f l = GDN_L4(35, 2); x35 -= l.x * x8; x35 -= l.y * x9; x35 -= l.z * x10; x35 -= l.w * x11; } { const v4f l = GDN_L4(35, 3); x35 -= l.x * x12; x35 -= l.y * x13; x35 -= l.z * x14; x35 -= l.w * x15; } { const v4f l = GDN_L4(35, 4); x35 -= l.x * x16; x35 -= l.y * x17; x35 -= l.z * x18; x35 -= l.w * x19; } { const v4f l = GDN_L4(35, 5); x35 -= l.x * x20; x35 -= l.y * x21; x35 -= l.z * x22; x35 -= l.w * x23; } { const v4f l = GDN_L4(35, 6); x35 -= l.x * x24; x35 -= l.y * x25; x35 -= l.z * x26; x35 -= l.w * x27; } { const v4f l = GDN_L4(35, 7); x35 -= l.x * x28; x35 -= l.y * x29; x35 -= l.z * x30; x35 -= l.w * x31; } { const v4f l = GDN_L4(35, 8); x35 -= l.x * x32; x35 -= l.y * x33; x35 -= l.z * x34; } __builtin_amdgcn_sched_barrier(0);
        float x36 = GDN_RHS(36); { const v4f l = GDN_L4(36, 0); x36 -= l.x * x0; x36 -= l.y * x1; x36 -= l.z * x2; x36 -= l.w * x3; } { const v4f l = GDN_L4(36, 1); x36 -= l.x * x4; x36 -= l.y * x5; x36 -= l.z * x6; x36 -= l.w * x7; } { const v4f l = GDN_L4(36, 2); x36 -= l.x * x8; x36 -= l.y * x9; x36 -= l.z * x10; x36 -= l.w * x11; } { const v4f l = GDN_L4(36, 3); x36 -= l.x * x12; x36 -= l.y * x13; x36 -= l.z * x14; x36 -= l.w * x15; } { const v4f l = GDN_L4(36, 4); x36 -= l.x * x16; x36 -= l.y * x17; x36 -= l.z * x18; x36 -= l.w * x19; } { const v4f l = GDN_L4(36, 5); x36 -= l.x * x20; x36 -= l.y * x21; x36 -= l.z * x22; x36 -= l.w * x23; } { const v4f l = GDN_L4(36, 6); x36 -= l.x * x24; x36 -= l.y * x25; x36 -= l.z * x26; x36 -= l.w * x27; } { const v4f l = GDN_L4(36, 7); x36 -= l.x * x28; x36 -= l.y * x29; x36 -= l.z * x30; x36 -= l.w * x31; } { const v4f l = GDN_L4(36, 8); x36 -= l.x * x32; x36 -= l.y * x33; x36 -= l.z * x34; x36 -= l.w * x35; } __builtin_amdgcn_sched_barrier(0);
        float x37 = GDN_RHS(37); { const v4f l = GDN_L4(37, 0); x37 -= l.x * x0; x37 -= l.y * x1; x37 -= l.z * x2; x37 -= l.w * x3; } { const v4f l = GDN_L4(37, 1); x37 -= l.x * x4; x37 -= l.y * x5; x37 -= l.z * x6; x37 -= l.w * x7; } { const v4f l = GDN_L4(37, 2); x37 -= l.x * x8; x37 -= l.y * x9; x37 -= l.z * x10; x37 -= l.w * x11; } { const v4f l = GDN_L4(37, 3); x37 -= l.x * x12; x37 -= l.y * x13; x37 -= l.z * x14; x37 -= l.w * x15; } { const v4f l = GDN_L4(37, 4); x37 -= l.x * x16; x37 -= l.y * x17; x37 -= l.z * x18; x37 -= l.w * x19; } { const v4f l = GDN_L4(37, 5); x37 -= l.x * x20; x37 -= l.y * x21; x37 -= l.z * x22; x37 -= l.w * x23; } { const v4f l = GDN_L4(37, 6); x37 -= l.x * x24; x37 -= l.y * x25; x37 -= l.z * x26; x37 -= l.w * x27; } { const v4f l = GDN_L4(37, 7); x37 -= l.x * x28; x37 -= l.y * x29; x37 -= l.z * x30; x37 -= l.w * x31; } { const v4f l = GDN_L4(37, 8); x37 -= l.x * x32; x37 -= l.y * x33; x37 -= l.z * x34; x37 -= l.w * x35; } { const v4f l = GDN_L4(37, 9); x37 -= l.x * x36; } __builtin_amdgcn_sched_barrier(0);
        float x38 = GDN_RHS(38); { const v4f l = GDN_L4(38, 0); x38 -= l.x * x0; x38 -= l.y * x1; x38 -= l.z * x2; x38 -= l.w * x3; } { const v4f l = GDN_L4(38, 1); x38 -= l.x * x4; x38 -= l.y * x5; x38 -= l.z * x6; x38 -= l.w * x7; } { const v4f l = GDN_L4(38, 2); x38 -= l.x * x8; x38 -= l.y * x9; x38 -= l.z * x10; x38 -= l.w * x11; } { const v4f l = GDN_L4(38, 3); x38 -= l.x * x12; x38 -= l.y * x13; x38 -= l.z * x14; x38 -= l.w * x15; } { const v4f l = GDN_L4(38, 4); x38 -= l.x * x16; x38 -= l.y * x17; x38 -= l.z * x18; x38 -= l.w * x19; } { const v4f l = GDN_L4(38, 5); x38 -= l.x * x20; x38 -= l.y * x21; x38 -= l.z * x22; x38 -= l.w * x23; } { const v4f l = GDN_L4(38, 6); x38 -= l.x * x24; x38 -= l.y * x25; x38 -= l.z * x26; x38 -= l.w * x27; } { const v4f l = GDN_L4(38, 7); x38 -= l.x * x28; x38 -= l.y * x29; x38 -= l.z * x30; x38 -= l.w * x31; } { const v4f l = GDN_L4(38, 8); x38 -= l.x * x32; x38 -= l.y * x33; x38 -= l.z * x34; x38 -= l.w * x35; } { const v4f l = GDN_L4(38, 9); x38 -= l.x * x36; x38 -= l.y * x37; } __builtin_amdgcn_sched_barrier(0);
        float x39 = GDN_RHS(39); { const v4f l = GDN_L4(39, 0); x39 -= l.x * x0; x39 -= l.y * x1; x39 -= l.z * x2; x39 -= l.w * x3; } { const v4f l = GDN_L4(39, 1); x39 -= l.x * x4; x39 -= l.y * x5; x39 -= l.z * x6; x39 -= l.w * x7; } { const v4f l = GDN_L4(39, 2); x39 -= l.x * x8; x39 -= l.y * x9; x39 -= l.z * x10; x39 -= l.w * x11; } { const v4f l = GDN_L4(39, 3); x39 -= l.x * x12; x39 -= l.y * x13; x39 -= l.z * x14; x39 -= l.w * x15; } { const v4f l = GDN_L4(39, 4); x39 -= l.x * x16; x39 -= l.y * x17; x39 -= l.z * x18; x39 -= l.w * x19; } { const v4f l = GDN_L4(39, 5); x39 -= l.x * x20; x39 -= l.y * x21; x39 -= l.z * x22; x39 -= l.w * x23; } { const v4f l = GDN_L4(39, 6); x39 -= l.x * x24; x39 -= l.y * x25; x39 -= l.z * x26; x39 -= l.w * x27; } { const v4f l = GDN_L4(39, 7); x39 -= l.x * x28; x39 -= l.y * x29; x39 -= l.z * x30; x39 -= l.w * x31; } { const v4f l = GDN_L4(39, 8); x39 -= l.x * x32; x39 -= l.y * x33; x39 -= l.z * x34; x39 -= l.w * x35; } { const v4f l = GDN_L4(39, 9); x39 -= l.x * x36; x39 -= l.y * x37; x39 -= l.z * x38; } __builtin_amdgcn_sched_barrier(0);
        float x40 = GDN_RHS(40); { const v4f l = GDN_L4(40, 0); x40 -= l.x * x0; x40 -= l.y * x1; x40 -= l.z * x2; x40 -= l.w * x3; } { const v4f l = GDN_L4(40, 1); x40 -= l.x * x4; x40 -= l.y * x5; x40 -= l.z * x6; x40 -= l.w * x7; } { const v4f l = GDN_L4(40, 2); x40 -= l.x * x8; x40 -= l.y * x9; x40 -= l.z * x10; x40 -= l.w * x11; } { const v4f l = GDN_L4(40, 3); x40 -= l.x * x12; x40 -= l.y * x13; x40 -= l.z * x14; x40 -= l.w * x15; } { const v4f l = GDN_L4(40, 4); x40 -= l.x * x16; x40 -= l.y * x17; x40 -= l.z * x18; x40 -= l.w * x19; } { const v4f l = GDN_L4(40, 5); x40 -= l.x * x20; x40 -= l.y * x21; x40 -= l.z * x22; x40 -= l.w * x23; } { const v4f l = GDN_L4(40, 6); x40 -= l.x * x24; x40 -= l.y * x25; x40 -= l.z * x26; x40 -= l.w * x27; } { const v4f l = GDN_L4(40, 7); x40 -= l.x * x28; x40 -= l.y * x29; x40 -= l.z * x30; x40 -= l.w * x31; } { const v4f l = GDN_L4(40, 8); x40 -= l.x * x32; x40 -= l.y * x33; x40 -= l.z * x34; x40 -= l.w * x35; } { const v4f l = GDN_L4(40, 9); x40 -= l.x * x36; x40 -= l.y * x37; x40 -= l.z * x38; x40 -= l.w * x39; } __builtin_amdgcn_sched_barrier(0);
        float x41 = GDN_RHS(41); { const v4f l = GDN_L4(41, 0); x41 -= l.x * x0; x41 -= l.y * x1; x41 -= l.z * x2; x41 -= l.w * x3; } { const v4f l = GDN_L4(41, 1); x41 -= l.x * x4; x41 -= l.y * x5; x41 -= l.z * x6; x41 -= l.w * x7; } { const v4f l = GDN_L4(41, 2); x41 -= l.x * x8; x41 -= l.y * x9; x41 -= l.z * x10; x41 -= l.w * x11; } { const v4f l = GDN_L4(41, 3); x41 -= l.x * x12; x41 -= l.y * x13; x41 -= l.z * x14; x41 -= l.w * x15; } { const v4f l = GDN_L4(41, 4); x41 -= l.x * x16; x41 -= l.y * x17; x41 -= l.z * x18; x41 -= l.w * x19; } { const v4f l = GDN_L4(41, 5); x41 -= l.x * x20; x41 -= l.y * x21; x41 -= l.z * x22; x41 -= l.w * x23; } { const v4f l = GDN_L4(41, 6); x41 -= l.x * x24; x41 -= l.y * x25; x41 -= l.z * x26; x41 -= l.w * x27; } { const v4f l = GDN_L4(41, 7); x41 -= l.x * x28; x41 -= l.y * x29; x41 -= l.z * x30; x41 -= l.w * x31; } { const v4f l = GDN_L4(41, 8); x41 -= l.x * x32; x41 -= l.y * x33; x41 -= l.z * x34; x41 -= l.w * x35; } { const v4f l = GDN_L4(41, 9); x41 -= l.x * x36; x41 -= l.y * x37; x41 -= l.z * x38; x41 -= l.w * x39; } { const v4f l = GDN_L4(41, 10); x41 -= l.x * x40; } __builtin_amdgcn_sched_barrier(0);
        float x42 = GDN_RHS(42); { const v4f l = GDN_L4(42, 0); x42 -= l.x * x0; x42 -= l.y * x1; x42 -= l.z * x2; x42 -= l.w * x3; } { const v4f l = GDN_L4(42, 1); x42 -= l.x * x4; x42 -= l.y * x5; x42 -= l.z * x6; x42 -= l.w * x7; } { const v4f l = GDN_L4(42, 2); x42 -= l.x * x8; x42 -= l.y * x9; x42 -= l.z * x10; x42 -= l.w * x11; } { const v4f l = GDN_L4(42, 3); x42 -= l.x * x12; x42 -= l.y * x13; x42 -= l.z * x14; x42 -= l.w * x15; } { const v4f l = GDN_L4(42, 4); x42 -= l.x * x16; x42 -= l.y * x17; x42 -= l.z * x18; x42 -= l.w * x19; } { const v4f l = GDN_L4(42, 5); x42 -= l.x * x20; x42 -= l.y * x21; x42 -= l.z * x22; x42 -= l.w * x23; } { const v4f l = GDN_L4(42, 6); x42 -= l.x * x24; x42 -= l.y * x25; x42 -= l.z * x26; x42 -= l.w * x27; } { const v4f l = GDN_L4(42, 7); x42 -= l.x * x28; x42 -= l.y * x29; x42 -= l.z * x30; x42 -= l.w * x31; } { const v4f l = GDN_L4(42, 8); x42 -= l.x * x32; x42 -= l.y * x33; x42 -= l.z * x34; x42 -= l.w * x35; } { const v4f l = GDN_L4(42, 9); x42 -= l.x * x36; x42 -= l.y * x37; x42 -= l.z * x38; x42 -= l.w * x39; } { const v4f l = GDN_L4(42, 10); x42 -= l.x * x40; x42 -= l.y * x41; } __builtin_amdgcn_sched_barrier(0);
        float x43 = GDN_RHS(43); { const v4f l = GDN_L4(43, 0); x43 -= l.x * x0; x43 -= l.y * x1; x43 -= l.z * x2; x43 -= l.w * x3; } { const v4f l = GDN_L4(43, 1); x43 -= l.x * x4; x43 -= l.y * x5; x43 -= l.z * x6; x43 -= l.w * x7; } { const v4f l = GDN_L4(43, 2); x43 -= l.x * x8; x43 -= l.y * x9; x43 -= l.z * x10; x43 -= l.w * x11; } { const v4f l = GDN_L4(43, 3); x43 -= l.x * x12; x43 -= l.y * x13; x43 -= l.z * x14; x43 -= l.w * x15; } { const v4f l = GDN_L4(43, 4); x43 -= l.x * x16; x43 -= l.y * x17; x43 -= l.z * x18; x43 -= l.w * x19; } { const v4f l = GDN_L4(43, 5); x43 -= l.x * x20; x43 -= l.y * x21; x43 -= l.z * x22; x43 -= l.w * x23; } { const v4f l = GDN_L4(43, 6); x43 -= l.x * x24; x43 -= l.y * x25; x43 -= l.z * x26; x43 -= l.w * x27; } { const v4f l = GDN_L4(43, 7); x43 -= l.x * x28; x43 -= l.y * x29; x43 -= l.z * x30; x43 -= l.w * x31; } { const v4f l = GDN_L4(43, 8); x43 -= l.x * x32; x43 -= l.y * x33; x43 -= l.z * x34; x43 -= l.w * x35; } { const v4f l = GDN_L4(43, 9); x43 -= l.x * x36; x43 -= l.y * x37; x43 -= l.z * x38; x43 -= l.w * x39; } { const v4f l = GDN_L4(43, 10); x43 -= l.x * x40; x43 -= l.y * x41; x43 -= l.z * x42; } __builtin_amdgcn_sched_barrier(0);
        float x44 = GDN_RHS(44); { const v4f l = GDN_L4(44, 0); x44 -= l.x * x0; x44 -= l.y * x1; x44 -= l.z * x2; x44 -= l.w * x3; } { const v4f l = GDN_L4(44, 1); x44 -= l.x * x4; x44 -= l.y * x5; x44 -= l.z * x6; x44 -= l.w * x7; } { const v4f l = GDN_L4(44, 2); x44 -= l.x * x8; x44 -= l.y * x9; x44 -= l.z * x10; x44 -= l.w * x11; } { const v4f l = GDN_L4(44, 3); x44 -= l.x * x12; x44 -= l.y * x13; x44 -= l.z * x14; x44 -= l.w * x15; } { const v4f l = GDN_L4(44, 4); x44 -= l.x * x16; x44 -= l.y * x17; x44 -= l.z * x18; x44 -= l.w * x19; } { const v4f l = GDN_L4(44, 5); x44 -= l.x * x20; x44 -= l.y * x21; x44 -= l.z * x22; x44 -= l.w * x23; } { const v4f l = GDN_L4(44, 6); x44 -= l.x * x24; x44 -= l.y * x25; x44 -= l.z * x26; x44 -= l.w * x27; } { const v4f l = GDN_L4(44, 7); x44 -= l.x * x28; x44 -= l.y * x29; x44 -= l.z * x30; x44 -= l.w * x31; } { const v4f l = GDN_L4(44, 8); x44 -= l.x * x32; x44 -= l.y * x33; x44 -= l.z * x34; x44 -= l.w * x35; } { const v4f l = GDN_L4(44, 9); x44 -= l.x * x36; x44 -= l.y * x37; x44 -= l.z * x38; x44 -= l.w * x39; } { const v4f l = GDN_L4(44, 10); x44 -= l.x * x40; x44 -= l.y * x41; x44 -= l.z * x42; x44 -= l.w * x43; } __builtin_amdgcn_sched_barrier(0);
        float x45 = GDN_RHS(45); { const v4f l = GDN_L4(45, 0); x45 -= l.x * x0; x45 -= l.y * x1; x45 -= l.z * x2; x45 -= l.w * x3; } { const v4f l = GDN_L4(45, 1); x45 -= l.x * x4; x45 -= l.y * x5; x45 -= l.z * x6; x45 -= l.w * x7; } { const v4f l = GDN_L4(45, 2); x45 -= l.x * x8; x45 -= l.y * x9; x45 -= l.z * x10; x45 -= l.w * x11; } { const v4f l = GDN_L4(45, 3); x45 -= l.x * x12; x45 -= l.y * x13; x45 -= l.z * x14; x45 -= l.w * x15; } { const v4f l = GDN_L4(45, 4); x45 -= l.x * x16; x45 -= l.y * x17; x45 -= l.z * x18; x45 -= l.w * x19; } { const v4f l = GDN_L4(45, 5); x45 -= l.x * x20; x45 -= l.y * x21; x45 -= l.z * x22; x45 -= l.w * x23; } { const v4f l = GDN_L4(45, 6); x45 -= l.x * x24; x45 -= l.y * x25; x45 -= l.z * x26; x45 -= l.w * x27; } { const v4f l = GDN_L4(45, 7); x45 -= l.x * x28; x45 -= l.y * x29; x45 -= l.z * x30; x45 -= l.w * x31; } { const v4f l = GDN_L4(45, 8); x45 -= l.x * x32; x45 -= l.y * x33; x45 -= l.z * x34; x45 -= l.w * x35; } { const v4f l = GDN_L4(45, 9); x45 -= l.x * x36; x45 -= l.y * x37; x45 -= l.z * x38; x45 -= l.w * x39; } { const v4f l = GDN_L4(45, 10); x45 -= l.x * x40; x45 -= l.y * x41; x45 -= l.z * x42; x45 -= l.w * x43; } { const v4f l = GDN_L4(45, 11); x45 -= l.x * x44; } __builtin_amdgcn_sched_barrier(0);
        float x46 = GDN_RHS(46); { const v4f l = GDN_L4(46, 0); x46 -= l.x * x0; x46 -= l.y * x1; x46 -= l.z * x2; x46 -= l.w * x3; } { const v4f l = GDN_L4(46, 1); x46 -= l.x * x4; x46 -= l.y * x5; x46 -= l.z * x6; x46 -= l.w * x7; } { const v4f l = GDN_L4(46, 2); x46 -= l.x * x8; x46 -= l.y * x9; x46 -= l.z * x10; x46 -= l.w * x11; } { const v4f l = GDN_L4(46, 3); x46 -= l.x * x12; x46 -= l.y * x13; x46 -= l.z * x14; x46 -= l.w * x15; } { const v4f l = GDN_L4(46, 4); x46 -= l.x * x16; x46 -= l.y * x17; x46 -= l.z * x18; x46 -= l.w * x19; } { const v4f l = GDN_L4(46, 5); x46 -= l.x * x20; x46 -= l.y * x21; x46 -= l.z * x22; x46 -= l.w * x23; } { const v4f l = GDN_L4(46, 6); x46 -= l.x * x24; x46 -= l.y * x25; x46 -= l.z * x26; x46 -= l.w * x27; } { const v4f l = GDN_L4(46, 7); x46 -= l.x * x28; x46 -= l.y * x29; x46 -= l.z * x30; x46 -= l.w * x31; } { const v4f l = GDN_L4(46, 8); x46 -= l.x * x32; x46 -= l.y * x33; x46 -= l.z * x34; x46 -= l.w * x35; } { const v4f l = GDN_L4(46, 9); x46 -= l.x * x36; x46 -= l.y * x37; x46 -= l.z * x38; x46 -= l.w * x39; } { const v4f l = GDN_L4(46, 10); x46 -= l.x * x40; x46 -= l.y * x41; x46 -= l.z * x42; x46 -= l.w * x43; } { const v4f l = GDN_L4(46, 11); x46 -= l.x * x44; x46 -= l.y * x45; } __builtin_amdgcn_sched_barrier(0);
        float x47 = GDN_RHS(47); { const v4f l = GDN_L4(47, 0); x47 -= l.x * x0; x47 -= l.y * x1; x47 -= l.z * x2; x47 -= l.w * x3; } { const v4f l = GDN_L4(47, 1); x47 -= l.x * x4; x47 -= l.y * x5; x47 -= l.z * x6; x47 -= l.w * x7; } { const v4f l = GDN_L4(47, 2); x47 -= l.x * x8; x47 -= l.y * x9; x47 -= l.z * x10; x47 -= l.w * x11; } { const v4f l = GDN_L4(47, 3); x47 -= l.x * x12; x47 -= l.y * x13; x47 -= l.z * x14; x47 -= l.w * x15; } { const v4f l = GDN_L4(47, 4); x47 -= l.x * x16; x47 -= l.y * x17; x47 -= l.z * x18; x47 -= l.w * x19; } { const v4f l = GDN_L4(47, 5); x47 -= l.x * x20; x47 -= l.y * x21; x47 -= l.z * x22; x47 -= l.w * x23; } { const v4f l = GDN_L4(47, 6); x47 -= l.x * x24; x47 -= l.y * x25; x47 -= l.z * x26; x47 -= l.w * x27; } { const v4f l = GDN_L4(47, 7); x47 -= l.x * x28; x47 -= l.y * x29; x47 -= l.z * x30; x47 -= l.w * x31; } { const v4f l = GDN_L4(47, 8); x47 -= l.x * x32; x47 -= l.y * x33; x47 -= l.z * x34; x47 -= l.w * x35; } { const v4f l = GDN_L4(47, 9); x47 -= l.x * x36; x47 -= l.y * x37; x47 -= l.z * x38; x47 -= l.w * x39; } { const v4f l = GDN_L4(47, 10); x47 -= l.x * x40; x47 -= l.y * x41; x47 -= l.z * x42; x47 -= l.w * x43; } { const v4f l = GDN_L4(47, 11); x47 -= l.x * x44; x47 -= l.y * x45; x47 -= l.z * x46; } __builtin_amdgcn_sched_barrier(0);
        float x48 = GDN_RHS(48); { const v4f l = GDN_L4(48, 0); x48 -= l.x * x0; x48 -= l.y * x1; x48 -= l.z * x2; x48 -= l.w * x3; } { const v4f l = GDN_L4(48, 1); x48 -= l.x * x4; x48 -= l.y * x5; x48 -= l.z * x6; x48 -= l.w * x7; } { const v4f l = GDN_L4(48, 2); x48 -= l.x * x8; x48 -= l.y * x9; x48 -= l.z * x10; x48 -= l.w * x11; } { const v4f l = GDN_L4(48, 3); x48 -= l.x * x12; x48 -= l.y * x13; x48 -= l.z * x14; x48 -= l.w * x15; } { const v4f l = GDN_L4(48, 4); x48 -= l.x * x16; x48 -= l.y * x17; x48 -= l.z * x18; x48 -= l.w * x19; } { const v4f l = GDN_L4(48, 5); x48 -= l.x * x20; x48 -= l.y * x21; x48 -= l.z * x22; x48 -= l.w * x23; } { const v4f l = GDN_L4(48, 6); x48 -= l.x * x24; x48 -= l.y * x25; x48 -= l.z * x26; x48 -= l.w * x27; } { const v4f l = GDN_L4(48, 7); x48 -= l.x * x28; x48 -= l.y * x29; x48 -= l.z * x30; x48 -= l.w * x31; } { const v4f l = GDN_L4(48, 8); x48 -= l.x * x32; x48 -= l.y * x33; x48 -= l.z * x34; x48 -= l.w * x35; } { const v4f l = GDN_L4(48, 9); x48 -= l.x * x36; x48 -= l.y * x37; x48 -= l.z * x38; x48 -= l.w * x39; } { const v4f l = GDN_L4(48, 10); x48 -= l.x * x40; x48 -= l.y * x41; x48 -= l.z * x42; x48 -= l.w * x43; } { const v4f l = GDN_L4(48, 11); x48 -= l.x * x44; x48 -= l.y * x45; x48 -= l.z * x46; x48 -= l.w * x47; } __builtin_amdgcn_sched_barrier(0);
        float x49 = GDN_RHS(49); { const v4f l = GDN_L4(49, 0); x49 -= l.x * x0; x49 -= l.y * x1; x49 -= l.z * x2; x49 -= l.w * x3; } { const v4f l = GDN_L4(49, 1); x49 -= l.x * x4; x49 -= l.y * x5; x49 -= l.z * x6; x49 -= l.w * x7; } { const v4f l = GDN_L4(49, 2); x49 -= l.x * x8; x49 -= l.y * x9; x49 -= l.z * x10; x49 -= l.w * x11; } { const v4f l = GDN_L4(49, 3); x49 -= l.x * x12; x49 -= l.y * x13; x49 -= l.z * x14; x49 -= l.w * x15; } { const v4f l = GDN_L4(49, 4); x49 -= l.x * x16; x49 -= l.y * x17; x49 -= l.z * x18; x49 -= l.w * x19; } { const v4f l = GDN_L4(49, 5); x49 -= l.x * x20; x49 -= l.y * x21; x49 -= l.z * x22; x49 -= l.w * x23; } { const v4f l = GDN_L4(49, 6); x49 -= l.x * x24; x49 -= l.y * x25; x49 -= l.z * x26; x49 -= l.w * x27; } { const v4f l = GDN_L4(49, 7); x49 -= l.x * x28; x49 -= l.y * x29; x49 -= l.z * x30; x49 -= l.w * x31; } { const v4f l = GDN_L4(49, 8); x49 -= l.x * x32; x49 -= l.y * x33; x49 -= l.z * x34; x49 -= l.w * x35; } { const v4f l = GDN_L4(49, 9); x49 -= l.x * x36; x49 -= l.y * x37; x49 -= l.z * x38; x49 -= l.w * x39; } { const v4f l = GDN_L4(49, 10); x49 -= l.x * x40; x49 -= l.y * x41; x49 -= l.z * x42; x49 -= l.w * x43; } { const v4f l = GDN_L4(49, 11); x49 -= l.x * x44; x49 -= l.y * x45; x49 -= l.z * x46; x49 -= l.w * x47; } { const v4f l = GDN_L4(49, 12); x49 -= l.x * x48; } __builtin_amdgcn_sched_barrier(0);
        float x50 = GDN_RHS(50); { const v4f l = GDN_L4(50, 0); x50 -= l.x * x0; x50 -= l.y * x1; x50 -= l.z * x2; x50 -= l.w * x3; } { const v4f l = GDN_L4(50, 1); x50 -= l.x * x4; x50 -= l.y * x5; x50 -= l.z * x6; x50 -= l.w * x7; } { const v4f l = GDN_L4(50, 2); x50 -= l.x * x8; x50 -= l.y * x9; x50 -= l.z * x10; x50 -= l.w * x11; } { const v4f l = GDN_L4(50, 3); x50 -= l.x * x12; x50 -= l.y * x13; x50 -= l.z * x14; x50 -= l.w * x15; } { const v4f l = GDN_L4(50, 4); x50 -= l.x * x16; x50 -= l.y * x17; x50 -= l.z * x18; x50 -= l.w * x19; } { const v4f l = GDN_L4(50, 5); x50 -= l.x * x20; x50 -= l.y * x21; x50 -= l.z * x22; x50 -= l.w * x23; } { const v4f l = GDN_L4(50, 6); x50 -= l.x * x24; x50 -= l.y * x25; x50 -= l.z * x26; x50 -= l.w * x27; } { const v4f l = GDN_L4(50, 7); x50 -= l.x * x28; x50 -= l.y * x29; x50 -= l.z * x30; x50 -= l.w * x31; } { const v4f l = GDN_L4(50, 8); x50 -= l.x * x32; x50 -= l.y * x33; x50 -= l.z * x34; x50 -= l.w * x35; } { const v4f l = GDN_L4(50, 9); x50 -= l.x * x36; x50 -= l.y * x37; x50 -= l.z * x38; x50 -= l.w * x39; } { const v4f l = GDN_L4(50, 10); x50 -= l.x * x40; x50 -= l.y * x41; x50 -= l.z * x42; x50 -= l.w * x43; } { const v4f l = GDN_L4(50, 11); x50 -= l.x * x44; x50 -= l.y * x45; x50 -= l.z * x46; x50 -= l.w * x47; } { const v4f l = GDN_L4(50, 12); x50 -= l.x * x48; x50 -= l.y * x49; } __builtin_amdgcn_sched_barrier(0);
        float x51 = GDN_RHS(51); { const v4f l = GDN_L4(51, 0); x51 -= l.x * x0; x51 -= l.y * x1; x51 -= l.z * x2; x51 -= l.w * x3; } { const v4f l = GDN_L4(51, 1); x51 -= l.x * x4; x51 -= l.y * x5; x51 -= l.z * x6; x51 -= l.w * x7; } { const v4f l = GDN_L4(51, 2); x51 -= l.x * x8; x51 -= l.y * x9; x51 -= l.z * x10; x51 -= l.w * x11; } { const v4f l = GDN_L4(51, 3); x51 -= l.x * x12; x51 -= l.y * x13; x51 -= l.z * x14; x51 -= l.w * x15; } { const v4f l = GDN_L4(51, 4); x51 -= l.x * x16; x51 -= l.y * x17; x51 -= l.z * x18; x51 -= l.w * x19; } { const v4f l = GDN_L4(51, 5); x51 -= l.x * x20; x51 -= l.y * x21; x51 -= l.z * x22; x51 -= l.w * x23; } { const v4f l = GDN_L4(51, 6); x51 -= l.x * x24; x51 -= l.y * x25; x51 -= l.z * x26; x51 -= l.w * x27; } { const v4f l = GDN_L4(51, 7); x51 -= l.x * x28; x51 -= l.y * x29; x51 -= l.z * x30; x51 -= l.w * x31; } { const v4f l = GDN_L4(51, 8); x51 -= l.x * x32; x51 -= l.y * x33; x51 -= l.z * x34; x51 -= l.w * x35; } { const v4f l = GDN_L4(51, 9); x51 -= l.x * x36; x51 -= l.y * x37; x51 -= l.z * x38; x51 -= l.w * x39; } { const v4f l = GDN_L4(51, 10); x51 -= l.x * x40; x51 -= l.y * x41; x51 -= l.z * x42; x51 -= l.w * x43; } { const v4f l = GDN_L4(51, 11); x51 -= l.x * x44; x51 -= l.y * x45; x51 -= l.z * x46; x51 -= l.w * x47; } { const v4f l = GDN_L4(51, 12); x51 -= l.x * x48; x51 -= l.y * x49; x51 -= l.z * x50; } __builtin_amdgcn_sched_barrier(0);
        float x52 = GDN_RHS(52); { const v4f l = GDN_L4(52, 0); x52 -= l.x * x0; x52 -= l.y * x1; x52 -= l.z * x2; x52 -= l.w * x3; } { const v4f l = GDN_L4(52, 1); x52 -= l.x * x4; x52 -= l.y * x5; x52 -= l.z * x6; x52 -= l.w * x7; } { const v4f l = GDN_L4(52, 2); x52 -= l.x * x8; x52 -= l.y * x9; x52 -= l.z * x10; x52 -= l.w * x11; } { const v4f l = GDN_L4(52, 3); x52 -= l.x * x12; x52 -= l.y * x13; x52 -= l.z * x14; x52 -= l.w * x15; } { const v4f l = GDN_L4(52, 4); x52 -= l.x * x16; x52 -= l.y * x17; x52 -= l.z * x18; x52 -= l.w * x19; } { const v4f l = GDN_L4(52, 5); x52 -= l.x * x20; x52 -= l.y * x21; x52 -= l.z * x22; x52 -= l.w * x23; } { const v4f l = GDN_L4(52, 6); x52 -= l.x * x24; x52 -= l.y * x25; x52 -= l.z * x26; x52 -= l.w * x27; } { const v4f l = GDN_L4(52, 7); x52 -= l.x * x28; x52 -= l.y * x29; x52 -= l.z * x30; x52 -= l.w * x31; } { const v4f l = GDN_L4(52, 8); x52 -= l.x * x32; x52 -= l.y * x33; x52 -= l.z * x34; x52 -= l.w * x35; } { const v4f l = GDN_L4(52, 9); x52 -= l.x * x36; x52 -= l.y * x37; x52 -= l.z * x38; x52 -= l.w * x39; } { const v4f l = GDN_L4(52, 10); x52 -= l.x * x40; x52 -= l.y * x41; x52 -= l.z * x42; x52 -= l.w * x43; } { const v4f l = GDN_L4(52, 11); x52 -= l.x * x44; x52 -= l.y * x45; x52 -= l.z * x46; x52 -= l.w * x47; } { const v4f l = GDN_L4(52, 12); x52 -= l.x * x48; x52 -= l.y * x49; x52 -= l.z * x50; x52 -= l.w * x51; } __builtin_amdgcn_sched_barrier(0);
        float x53 = GDN_RHS(53); { const v4f l = GDN_L4(53, 0); x53 -= l.x * x0; x53 -= l.y * x1; x53 -= l.z * x2; x53 -= l.w * x3; } { const v4f l = GDN_L4(53, 1); x53 -= l.x * x4; x53 -= l.y * x5; x53 -= l.z * x6; x53 -= l.w * x7; } { const v4f l = GDN_L4(53, 2); x53 -= l.x * x8; x53 -= l.y * x9; x53 -= l.z * x10; x53 -= l.w * x11; } { const v4f l = GDN_L4(53, 3); x53 -= l.x * x12; x53 -= l.y * x13; x53 -= l.z * x14; x53 -= l.w * x15; } { const v4f l = GDN_L4(53, 4); x53 -= l.x * x16; x53 -= l.y * x17; x53 -= l.z * x18; x53 -= l.w * x19; } { const v4f l = GDN_L4(53, 5); x53 -= l.x * x20; x53 -= l.y * x21; x53 -= l.z * x22; x53 -= l.w * x23; } { const v4f l = GDN_L4(53, 6); x53 -= l.x * x24; x53 -= l.y * x25; x53 -= l.z * x26; x53 -= l.w * x27; } { const v4f l = GDN_L4(53, 7); x53 -= l.x * x28; x53 -= l.y * x29; x53 -= l.z * x30; x53 -= l.w * x31; } { const v4f l = GDN_L4(53, 8); x53 -= l.x * x32; x53 -= l.y * x33; x53 -= l.z * x34; x53 -= l.w * x35; } { const v4f l = GDN_L4(53, 9); x53 -= l.x * x36; x53 -= l.y * x37; x53 -= l.z * x38; x53 -= l.w * x39; } { const v4f l = GDN_L4(53, 10); x53 -= l.x * x40; x53 -= l.y * x41; x53 -= l.z * x42; x53 -= l.w * x43; } { const v4f l = GDN_L4(53, 11); x53 -= l.x * x44; x53 -= l.y * x45; x53 -= l.z * x46; x53 -= l.w * x47; } { const v4f l = GDN_L4(53, 12); x53 -= l.x * x48; x53 -= l.y * x49; x53 -= l.z * x50; x53 -= l.w * x51; } { const v4f l = GDN_L4(53, 13); x53 -= l.x * x52; } __builtin_amdgcn_sched_barrier(0);
        float x54 = GDN_RHS(54); { const v4f l = GDN_L4(54, 0); x54 -= l.x * x0; x54 -= l.y * x1; x54 -= l.z * x2; x54 -= l.w * x3; } { const v4f l = GDN_L4(54, 1); x54 -= l.x * x4; x54 -= l.y * x5; x54 -= l.z * x6; x54 -= l.w * x7; } { const v4f l = GDN_L4(54, 2); x54 -= l.x * x8; x54 -= l.y * x9; x54 -= l.z * x10; x54 -= l.w * x11; } { const v4f l = GDN_L4(54, 3); x54 -= l.x * x12; x54 -= l.y * x13; x54 -= l.z * x14; x54 -= l.w * x15; } { const v4f l = GDN_L4(54, 4); x54 -= l.x * x16; x54 -= l.y * x17; x54 -= l.z * x18; x54 -= l.w * x19; } { const v4f l = GDN_L4(54, 5); x54 -= l.x * x20; x54 -= l.y * x21; x54 -= l.z * x22; x54 -= l.w * x23; } { const v4f l = GDN_L4(54, 6); x54 -= l.x * x24; x54 -= l.y * x25; x54 -= l.z * x26; x54 -= l.w * x27; } { const v4f l = GDN_L4(54, 7); x54 -= l.x * x28; x54 -= l.y * x29; x54 -= l.z * x30; x54 -= l.w * x31; } { const v4f l = GDN_L4(54, 8); x54 -= l.x * x32; x54 -= l.y * x33; x54 -= l.z * x34; x54 -= l.w * x35; } { const v4f l = GDN_L4(54, 9); x54 -= l.x * x36; x54 -= l.y * x37; x54 -= l.z * x38; x54 -= l.w * x39; } { const v4f l = GDN_L4(54, 10); x54 -= l.x * x40; x54 -= l.y * x41; x54 -= l.z * x42; x54 -= l.w * x43; } { const v4f l = GDN_L4(54, 11); x54 -= l.x * x44; x54 -= l.y * x45; x54 -= l.z * x46; x54 -= l.w * x47; } { const v4f l = GDN_L4(54, 12); x54 -= l.x * x48; x54 -= l.y * x49; x54 -= l.z * x50; x54 -= l.w * x51; } { const v4f l = GDN_L4(54, 13); x54 -= l.x * x52; x54 -= l.y * x53; } __builtin_amdgcn_sched_barrier(0);
        float x55 = GDN_RHS(55); { const v4f l = GDN_L4(55, 0); x55 -= l.x * x0; x55 -= l.y * x1; x55 -= l.z * x2; x55 -= l.w * x3; } { const v4f l = GDN_L4(55, 1); x55 -= l.x * x4; x55 -= l.y * x5; x55 -= l.z * x6; x55 -= l.w * x7; } { const v4f l = GDN_L4(55, 2); x55 -= l.x * x8; x55 -= l.y * x9; x55 -= l.z * x10; x55 -= l.w * x11; } { const v4f l = GDN_L4(55, 3); x55 -= l.x * x12; x55 -= l.y * x13; x55 -= l.z * x14; x55 -= l.w * x15; } { const v4f l = GDN_L4(55, 4); x55 -= l.x * x16; x55 -= l.y * x17; x55 -= l.z * x18; x55 -= l.w * x19; } { const v4f l = GDN_L4(55, 5); x55 -= l.x * x20; x55 -= l.y * x21; x55 -= l.z * x22; x55 -= l.w * x23; } { const v4f l = GDN_L4(55, 6); x55 -= l.x * x24; x55 -= l.y * x25; x55 -= l.z * x26; x55 -= l.w * x27; } { const v4f l = GDN_L4(55, 7); x55 -= l.x * x28; x55 -= l.y * x29; x55 -= l.z * x30; x55 -= l.w * x31; } { const v4f l = GDN_L4(55, 8); x55 -= l.x * x32; x55 -= l.y * x33; x55 -= l.z * x34; x55 -= l.w * x35; } { const v4f l = GDN_L4(55, 9); x55 -= l.x * x36; x55 -= l.y * x37; x55 -= l.z * x38; x55 -= l.w * x39; } { const v4f l = GDN_L4(55, 10); x55 -= l.x * x40; x55 -= l.y * x41; x55 -= l.z * x42; x55 -= l.w * x43; } { const v4f l = GDN_L4(55, 11); x55 -= l.x * x44; x55 -= l.y * x45; x55 -= l.z * x46; x55 -= l.w * x47; } { const v4f l = GDN_L4(55, 12); x55 -= l.x * x48; x55 -= l.y * x49; x55 -= l.z * x50; x55 -= l.w * x51; } { const v4f l = GDN_L4(55, 13); x55 -= l.x * x52; x55 -= l.y * x53; x55 -= l.z * x54; } __builtin_amdgcn_sched_barrier(0);
        float x56 = GDN_RHS(56); { const v4f l = GDN_L4(56, 0); x56 -= l.x * x0; x56 -= l.y * x1; x56 -= l.z * x2; x56 -= l.w * x3; } { const v4f l = GDN_L4(56, 1); x56 -= l.x * x4; x56 -= l.y * x5; x56 -= l.z * x6; x56 -= l.w * x7; } { const v4f l = GDN_L4(56, 2); x56 -= l.x * x8; x56 -= l.y * x9; x56 -= l.z * x10; x56 -= l.w * x11; } { const v4f l = GDN_L4(56, 3); x56 -= l.x * x12; x56 -= l.y * x13; x56 -= l.z * x14; x56 -= l.w * x15; } { const v4f l = GDN_L4(56, 4); x56 -= l.x * x16; x56 -= l.y * x17; x56 -= l.z * x18; x56 -= l.w * x19; } { const v4f l = GDN_L4(56, 5); x56 -= l.x * x20; x56 -= l.y * x21; x56 -= l.z * x22; x56 -= l.w * x23; } { const v4f l = GDN_L4(56, 6); x56 -= l.x * x24; x56 -= l.y * x25; x56 -= l.z * x26; x56 -= l.w * x27; } { const v4f l = GDN_L4(56, 7); x56 -= l.x * x28; x56 -= l.y * x29; x56 -= l.z * x30; x56 -= l.w * x31; } { const v4f l = GDN_L4(56, 8); x56 -= l.x * x32; x56 -= l.y * x33; x56 -= l.z * x34; x56 -= l.w * x35; } { const v4f l = GDN_L4(56, 9); x56 -= l.x * x36; x56 -= l.y * x37; x56 -= l.z * x38; x56 -= l.w * x39; } { const v4f l = GDN_L4(56, 10); x56 -= l.x * x40; x56 -= l.y * x41; x56 -= l.z * x42; x56 -= l.w * x43; } { const v4f l = GDN_L4(56, 11); x56 -= l.x * x44; x56 -= l.y * x45; x56 -= l.z * x46; x56 -= l.w * x47; } { const v4f l = GDN_L4(56, 12); x56 -= l.x * x48; x56 -= l.y * x49; x56 -= l.z * x50; x56 -= l.w * x51; } { const v4f l = GDN_L4(56, 13); x56 -= l.x * x52; x56 -= l.y * x53; x56 -= l.z * x54; x56 -= l.w * x55; } __builtin_amdgcn_sched_barrier(0);
        float x57 = GDN_RHS(57); { const v4f l = GDN_L4(57, 0); x57 -= l.x * x0; x57 -= l.y * x1; x57 -= l.z * x2; x57 -= l.w * x3; } { const v4f l = GDN_L4(57, 1); x57 -= l.x * x4; x57 -= l.y * x5; x57 -= l.z * x6; x57 -= l.w * x7; } { const v4f l = GDN_L4(57, 2); x57 -= l.x * x8; x57 -= l.y * x9; x57 -= l.z * x10; x57 -= l.w * x11; } { const v4f l = GDN_L4(57, 3); x57 -= l.x * x12; x57 -= l.y * x13; x57 -= l.z * x14; x57 -= l.w * x15; } { const v4f l = GDN_L4(57, 4); x57 -= l.x * x16; x57 -= l.y * x17; x57 -= l.z * x18; x57 -= l.w * x19; } { const v4f l = GDN_L4(57, 5); x57 -= l.x * x20; x57 -= l.y * x21; x57 -= l.z * x22; x57 -= l.w * x23; } { const v4f l = GDN_L4(57, 6); x57 -= l.x * x24; x57 -= l.y * x25; x57 -= l.z * x26; x57 -= l.w * x27; } { const v4f l = GDN_L4(57, 7); x57 -= l.x * x28; x57 -= l.y * x29; x57 -= l.z * x30; x57 -= l.w * x31; } { const v4f l = GDN_L4(57, 8); x57 -= l.x * x32; x57 -= l.y * x33; x57 -= l.z * x34; x57 -= l.w * x35; } { const v4f l = GDN_L4(57, 9); x57 -= l.x * x36; x57 -= l.y * x37; x57 -= l.z * x38; x57 -= l.w * x39; } { const v4f l = GDN_L4(57, 10); x57 -= l.x * x40; x57 -= l.y * x41; x57 -= l.z * x42; x57 -= l.w * x43; } { const v4f l = GDN_L4(57, 11); x57 -= l.x * x44; x57 -= l.y * x45; x57 -= l.z * x46; x57 -= l.w * x47; } { const v4f l = GDN_L4(57, 12); x57 -= l.x * x48; x57 -= l.y * x49; x57 -= l.z * x50; x57 -= l.w * x51; } { const v4f l = GDN_L4(57, 13); x57 -= l.x * x52; x57 -= l.y * x53; x57 -= l.z * x54; x57 -= l.w * x55; } { const v4f l = GDN_L4(57, 14); x57 -= l.x * x56; } __builtin_amdgcn_sched_barrier(0);
        float x58 = GDN_RHS(58); { const v4f l = GDN_L4(58, 0); x58 -= l.x * x0; x58 -= l.y * x1; x58 -= l.z * x2; x58 -= l.w * x3; } { const v4f l = GDN_L4(58, 1); x58 -= l.x * x4; x58 -= l.y * x5; x58 -= l.z * x6; x58 -= l.w * x7; } { const v4f l = GDN_L4(58, 2); x58 -= l.x * x8; x58 -= l.y * x9; x58 -= l.z * x10; x58 -= l.w * x11; } { const v4f l = GDN_L4(58, 3); x58 -= l.x * x12; x58 -= l.y * x13; x58 -= l.z * x14; x58 -= l.w * x15; } { const v4f l = GDN_L4(58, 4); x58 -= l.x * x16; x58 -= l.y * x17; x58 -= l.z * x18; x58 -= l.w * x19; } { const v4f l = GDN_L4(58, 5); x58 -= l.x * x20; x58 -= l.y * x21; x58 -= l.z * x22; x58 -= l.w * x23; } { const v4f l = GDN_L4(58, 6); x58 -= l.x * x24; x58 -= l.y * x25; x58 -= l.z * x26; x58 -= l.w * x27; } { const v4f l = GDN_L4(58, 7); x58 -= l.x * x28; x58 -= l.y * x29; x58 -= l.z * x30; x58 -= l.w * x31; } { const v4f l = GDN_L4(58, 8); x58 -= l.x * x32; x58 -= l.y * x33; x58 -= l.z * x34; x58 -= l.w * x35; } { const v4f l = GDN_L4(58, 9); x58 -= l.x * x36; x58 -= l.y * x37; x58 -= l.z * x38; x58 -= l.w * x39; } { const v4f l = GDN_L4(58, 10); x58 -= l.x * x40; x58 -= l.y * x41; x58 -= l.z * x42; x58 -= l.w * x43; } { const v4f l = GDN_L4(58, 11); x58 -= l.x * x44; x58 -= l.y * x45; x58 -= l.z * x46; x58 -= l.w * x47; } { const v4f l = GDN_L4(58, 12); x58 -= l.x * x48; x58 -= l.y * x49; x58 -= l.z * x50; x58 -= l.w * x51; } { const v4f l = GDN_L4(58, 13); x58 -= l.x * x52; x58 -= l.y * x53; x58 -= l.z * x54; x58 -= l.w * x55; } { const v4f l = GDN_L4(58, 14); x58 -= l.x * x56; x58 -= l.y * x57; } __builtin_amdgcn_sched_barrier(0);
        float x59 = GDN_RHS(59); { const v4f l = GDN_L4(59, 0); x59 -= l.x * x0; x59 -= l.y * x1; x59 -= l.z * x2; x59 -= l.w * x3; } { const v4f l = GDN_L4(59, 1); x59 -= l.x * x4; x59 -= l.y * x5; x59 -= l.z * x6; x59 -= l.w * x7; } { const v4f l = GDN_L4(59, 2); x59 -= l.x * x8; x59 -= l.y * x9; x59 -= l.z * x10; x59 -= l.w * x11; } { const v4f l = GDN_L4(59, 3); x59 -= l.x * x12; x59 -= l.y * x13; x59 -= l.z * x14; x59 -= l.w * x15; } { const v4f l = GDN_L4(59, 4); x59 -= l.x * x16; x59 -= l.y * x17; x59 -= l.z * x18; x59 -= l.w * x19; } { const v4f l = GDN_L4(59, 5); x59 -= l.x * x20; x59 -= l.y * x21; x59 -= l.z * x22; x59 -= l.w * x23; } { const v4f l = GDN_L4(59, 6); x59 -= l.x * x24; x59 -= l.y * x25; x59 -= l.z * x26; x59 -= l.w * x27; } { const v4f l = GDN_L4(59, 7); x59 -= l.x * x28; x59 -= l.y * x29; x59 -= l.z * x30; x59 -= l.w * x31; } { const v4f l = GDN_L4(59, 8); x59 -= l.x * x32; x59 -= l.y * x33; x59 -= l.z * x34; x59 -= l.w * x35; } { const v4f l = GDN_L4(59, 9); x59 -= l.x * x36; x59 -= l.y * x37; x59 -= l.z * x38; x59 -= l.w * x39; } { const v4f l = GDN_L4(59, 10); x59 -= l.x * x40; x59 -= l.y * x41; x59 -= l.z * x42; x59 -= l.w * x43; } { const v4f l = GDN_L4(59, 11); x59 -= l.x * x44; x59 -= l.y * x45; x59 -= l.z * x46; x59 -= l.w * x47; } { const v4f l = GDN_L4(59, 12); x59 -= l.x * x48; x59 -= l.y * x49; x59 -= l.z * x50; x59 -= l.w * x51; } { const v4f l = GDN_L4(59, 13); x59 -= l.x * x52; x59 -= l.y * x53; x59 -= l.z * x54; x59 -= l.w * x55; } { const v4f l = GDN_L4(59, 14); x59 -= l.x * x56; x59 -= l.y * x57; x59 -= l.z * x58; } __builtin_amdgcn_sched_barrier(0);
        float x60 = GDN_RHS(60); { const v4f l = GDN_L4(60, 0); x60 -= l.x * x0; x60 -= l.y * x1; x60 -= l.z * x2; x60 -= l.w * x3; } { const v4f l = GDN_L4(60, 1); x60 -= l.x * x4; x60 -= l.y * x5; x60 -= l.z * x6; x60 -= l.w * x7; } { const v4f l = GDN_L4(60, 2); x60 -= l.x * x8; x60 -= l.y * x9; x60 -= l.z * x10; x60 -= l.w * x11; } { const v4f l = GDN_L4(60, 3); x60 -= l.x * x12; x60 -= l.y * x13; x60 -= l.z * x14; x60 -= l.w * x15; } { const v4f l = GDN_L4(60, 4); x60 -= l.x * x16; x60 -= l.y * x17; x60 -= l.z * x18; x60 -= l.w * x19; } { const v4f l = GDN_L4(60, 5); x60 -= l.x * x20; x60 -= l.y * x21; x60 -= l.z * x22; x60 -= l.w * x23; } { const v4f l = GDN_L4(60, 6); x60 -= l.x * x24; x60 -= l.y * x25; x60 -= l.z * x26; x60 -= l.w * x27; } { const v4f l = GDN_L4(60, 7); x60 -= l.x * x28; x60 -= l.y * x29; x60 -= l.z * x30; x60 -= l.w * x31; } { const v4f l = GDN_L4(60, 8); x60 -= l.x * x32; x60 -= l.y * x33; x60 -= l.z * x34; x60 -= l.w * x35; } { const v4f l = GDN_L4(60, 9); x60 -= l.x * x36; x60 -= l.y * x37; x60 -= l.z * x38; x60 -= l.w * x39; } { const v4f l = GDN_L4(60, 10); x60 -= l.x * x40; x60 -= l.y * x41; x60 -= l.z * x42; x60 -= l.w * x43; } { const v4f l = GDN_L4(60, 11); x60 -= l.x * x44; x60 -= l.y * x45; x60 -= l.z * x46; x60 -= l.w * x47; } { const v4f l = GDN_L4(60, 12); x60 -= l.x * x48; x60 -= l.y * x49; x60 -= l.z * x50; x60 -= l.w * x51; } { const v4f l = GDN_L4(60, 13); x60 -= l.x * x52; x60 -= l.y * x53; x60 -= l.z * x54; x60 -= l.w * x55; } { const v4f l = GDN_L4(60, 14); x60 -= l.x * x56; x60 -= l.y * x57; x60 -= l.z * x58; x60 -= l.w * x59; } __builtin_amdgcn_sched_barrier(0);
        float x61 = GDN_RHS(61); { const v4f l = GDN_L4(61, 0); x61 -= l.x * x0; x61 -= l.y * x1; x61 -= l.z * x2; x61 -= l.w * x3; } { const v4f l = GDN_L4(61, 1); x61 -= l.x * x4; x61 -= l.y * x5; x61 -= l.z * x6; x61 -= l.w * x7; } { const v4f l = GDN_L4(61, 2); x61 -= l.x * x8; x61 -= l.y * x9; x61 -= l.z * x10; x61 -= l.w * x11; } { const v4f l = GDN_L4(61, 3); x61 -= l.x * x12; x61 -= l.y * x13; x61 -= l.z * x14; x61 -= l.w * x15; } { const v4f l = GDN_L4(61, 4); x61 -= l.x * x16; x61 -= l.y * x17; x61 -= l.z * x18; x61 -= l.w * x19; } { const v4f l = GDN_L4(61, 5); x61 -= l.x * x20; x61 -= l.y * x21; x61 -= l.z * x22; x61 -= l.w * x23; } { const v4f l = GDN_L4(61, 6); x61 -= l.x * x24; x61 -= l.y * x25; x61 -= l.z * x26; x61 -= l.w * x27; } { const v4f l = GDN_L4(61, 7); x61 -= l.x * x28; x61 -= l.y * x29; x61 -= l.z * x30; x61 -= l.w * x31; } { const v4f l = GDN_L4(61, 8); x61 -= l.x * x32; x61 -= l.y * x33; x61 -= l.z * x34; x61 -= l.w * x35; } { const v4f l = GDN_L4(61, 9); x61 -= l.x * x36; x61 -= l.y * x37; x61 -= l.z * x38; x61 -= l.w * x39; } { const v4f l = GDN_L4(61, 10); x61 -= l.x * x40; x61 -= l.y * x41; x61 -= l.z * x42; x61 -= l.w * x43; } { const v4f l = GDN_L4(61, 11); x61 -= l.x * x44; x61 -= l.y * x45; x61 -= l.z * x46; x61 -= l.w * x47; } { const v4f l = GDN_L4(61, 12); x61 -= l.x * x48; x61 -= l.y * x49; x61 -= l.z * x50; x61 -= l.w * x51; } { const v4f l = GDN_L4(61, 13); x61 -= l.x * x52; x61 -= l.y * x53; x61 -= l.z * x54; x61 -= l.w * x55; } { const v4f l = GDN_L4(61, 14); x61 -= l.x * x56; x61 -= l.y * x57; x61 -= l.z * x58; x61 -= l.w * x59; } { const v4f l = GDN_L4(61, 15); x61 -= l.x * x60; } __builtin_amdgcn_sched_barrier(0);
        float x62 = GDN_RHS(62); { const v4f l = GDN_L4(62, 0); x62 -= l.x * x0; x62 -= l.y * x1; x62 -= l.z * x2; x62 -= l.w * x3; } { const v4f l = GDN_L4(62, 1); x62 -= l.x * x4; x62 -= l.y * x5; x62 -= l.z * x6; x62 -= l.w * x7; } { const v4f l = GDN_L4(62, 2); x62 -= l.x * x8; x62 -= l.y * x9; x62 -= l.z * x10; x62 -= l.w * x11; } { const v4f l = GDN_L4(62, 3); x62 -= l.x * x12; x62 -= l.y * x13; x62 -= l.z * x14; x62 -= l.w * x15; } { const v4f l = GDN_L4(62, 4); x62 -= l.x * x16; x62 -= l.y * x17; x62 -= l.z * x18; x62 -= l.w * x19; } { const v4f l = GDN_L4(62, 5); x62 -= l.x * x20; x62 -= l.y * x21; x62 -= l.z * x22; x62 -= l.w * x23; } { const v4f l = GDN_L4(62, 6); x62 -= l.x * x24; x62 -= l.y * x25; x62 -= l.z * x26; x62 -= l.w * x27; } { const v4f l = GDN_L4(62, 7); x62 -= l.x * x28; x62 -= l.y * x29; x62 -= l.z * x30; x62 -= l.w * x31; } { const v4f l = GDN_L4(62, 8); x62 -= l.x * x32; x62 -= l.y * x33; x62 -= l.z * x34; x62 -= l.w * x35; } { const v4f l = GDN_L4(62, 9); x62 -= l.x * x36; x62 -= l.y * x37; x62 -= l.z * x38; x62 -= l.w * x39; } { const v4f l = GDN_L4(62, 10); x62 -= l.x * x40; x62 -= l.y * x41; x62 -= l.z * x42; x62 -= l.w * x43; } { const v4f l = GDN_L4(62, 11); x62 -= l.x * x44; x62 -= l.y * x45; x62 -= l.z * x46; x62 -= l.w * x47; } { const v4f l = GDN_L4(62, 12); x62 -= l.x * x48; x62 -= l.y * x49; x62 -= l.z * x50; x62 -= l.w * x51; } { const v4f l = GDN_L4(62, 13); x62 -= l.x * x52; x62 -= l.y * x53; x62 -= l.z * x54; x62 -= l.w * x55; } { const v4f l = GDN_L4(62, 14); x62 -= l.x * x56; x62 -= l.y * x57; x62 -= l.z * x58; x62 -= l.w * x59; } { const v4f l = GDN_L4(62, 15); x62 -= l.x * x60; x62 -= l.y * x61; } __builtin_amdgcn_sched_barrier(0);
        float x63 = GDN_RHS(63); { const v4f l = GDN_L4(63, 0); x63 -= l.x * x0; x63 -= l.y * x1; x63 -= l.z * x2; x63 -= l.w * x3; } { const v4f l = GDN_L4(63, 1); x63 -= l.x * x4; x63 -= l.y * x5; x63 -= l.z * x6; x63 -= l.w * x7; } { const v4f l = GDN_L4(63, 2); x63 -= l.x * x8; x63 -= l.y * x9; x63 -= l.z * x10; x63 -= l.w * x11; } { const v4f l = GDN_L4(63, 3); x63 -= l.x * x12; x63 -= l.y * x13; x63 -= l.z * x14; x63 -= l.w * x15; } { const v4f l = GDN_L4(63, 4); x63 -= l.x * x16; x63 -= l.y * x17; x63 -= l.z * x18; x63 -= l.w * x19; } { const v4f l = GDN_L4(63, 5); x63 -= l.x * x20; x63 -= l.y * x21; x63 -= l.z * x22; x63 -= l.w * x23; } { const v4f l = GDN_L4(63, 6); x63 -= l.x * x24; x63 -= l.y * x25; x63 -= l.z * x26; x63 -= l.w * x27; } { const v4f l = GDN_L4(63, 7); x63 -= l.x * x28; x63 -= l.y * x29; x63 -= l.z * x30; x63 -= l.w * x31; } { const v4f l = GDN_L4(63, 8); x63 -= l.x * x32; x63 -= l.y * x33; x63 -= l.z * x34; x63 -= l.w * x35; } { const v4f l = GDN_L4(63, 9); x63 -= l.x * x36; x63 -= l.y * x37; x63 -= l.z * x38; x63 -= l.w * x39; } { const v4f l = GDN_L4(63, 10); x63 -= l.x * x40; x63 -= l.y * x41; x63 -= l.z * x42; x63 -= l.w * x43; } { const v4f l = GDN_L4(63, 11); x63 -= l.x * x44; x63 -= l.y * x45; x63 -= l.z * x46; x63 -= l.w * x47; } { const v4f l = GDN_L4(63, 12); x63 -= l.x * x48; x63 -= l.y * x49; x63 -= l.z * x50; x63 -= l.w * x51; } { const v4f l = GDN_L4(63, 13); x63 -= l.x * x52; x63 -= l.y * x53; x63 -= l.z * x54; x63 -= l.w * x55; } { const v4f l = GDN_L4(63, 14); x63 -= l.x * x56; x63 -= l.y * x57; x63 -= l.z * x58; x63 -= l.w * x59; } { const v4f l = GDN_L4(63, 15); x63 -= l.x * x60; x63 -= l.y * x61; x63 -= l.z * x62; } __builtin_amdgcn_sched_barrier(0);
        if (c < 128) { GU[0 * 128 + c] = x0; GU[1 * 128 + c] = x1; GU[2 * 128 + c] = x2; GU[3 * 128 + c] = x3; GU[4 * 128 + c] = x4; GU[5 * 128 + c] = x5; GU[6 * 128 + c] = x6; GU[7 * 128 + c] = x7; GU[8 * 128 + c] = x8; GU[9 * 128 + c] = x9; GU[10 * 128 + c] = x10; GU[11 * 128 + c] = x11; GU[12 * 128 + c] = x12; GU[13 * 128 + c] = x13; GU[14 * 128 + c] = x14; GU[15 * 128 + c] = x15; GU[16 * 128 + c] = x16; GU[17 * 128 + c] = x17; GU[18 * 128 + c] = x18; GU[19 * 128 + c] = x19; GU[20 * 128 + c] = x20; GU[21 * 128 + c] = x21; GU[22 * 128 + c] = x22; GU[23 * 128 + c] = x23; GU[24 * 128 + c] = x24; GU[25 * 128 + c] = x25; GU[26 * 128 + c] = x26; GU[27 * 128 + c] = x27; GU[28 * 128 + c] = x28; GU[29 * 128 + c] = x29; GU[30 * 128 + c] = x30; GU[31 * 128 + c] = x31; GU[32 * 128 + c] = x32; GU[33 * 128 + c] = x33; GU[34 * 128 + c] = x34; GU[35 * 128 + c] = x35; GU[36 * 128 + c] = x36; GU[37 * 128 + c] = x37; GU[38 * 128 + c] = x38; GU[39 * 128 + c] = x39; GU[40 * 128 + c] = x40; GU[41 * 128 + c] = x41; GU[42 * 128 + c] = x42; GU[43 * 128 + c] = x43; GU[44 * 128 + c] = x44; GU[45 * 128 + c] = x45; GU[46 * 128 + c] = x46; GU[47 * 128 + c] = x47; GU[48 * 128 + c] = x48; GU[49 * 128 + c] = x49; GU[50 * 128 + c] = x50; GU[51 * 128 + c] = x51; GU[52 * 128 + c] = x52; GU[53 * 128 + c] = x53; GU[54 * 128 + c] = x54; GU[55 * 128 + c] = x55; GU[56 * 128 + c] = x56; GU[57 * 128 + c] = x57; GU[58 * 128 + c] = x58; GU[59 * 128 + c] = x59; GU[60 * 128 + c] = x60; GU[61 * 128 + c] = x61; GU[62 * 128 + c] = x62; GU[63 * 128 + c] = x63; }
        else { GNW[0 * 128 + (c - 128)] = (bf16)f2bf(-x0); GNW[1 * 128 + (c - 128)] = (bf16)f2bf(-x1); GNW[2 * 128 + (c - 128)] = (bf16)f2bf(-x2); GNW[3 * 128 + (c - 128)] = (bf16)f2bf(-x3); GNW[4 * 128 + (c - 128)] = (bf16)f2bf(-x4); GNW[5 * 128 + (c - 128)] = (bf16)f2bf(-x5); GNW[6 * 128 + (c - 128)] = (bf16)f2bf(-x6); GNW[7 * 128 + (c - 128)] = (bf16)f2bf(-x7); GNW[8 * 128 + (c - 128)] = (bf16)f2bf(-x8); GNW[9 * 128 + (c - 128)] = (bf16)f2bf(-x9); GNW[10 * 128 + (c - 128)] = (bf16)f2bf(-x10); GNW[11 * 128 + (c - 128)] = (bf16)f2bf(-x11); GNW[12 * 128 + (c - 128)] = (bf16)f2bf(-x12); GNW[13 * 128 + (c - 128)] = (bf16)f2bf(-x13); GNW[14 * 128 + (c - 128)] = (bf16)f2bf(-x14); GNW[15 * 128 + (c - 128)] = (bf16)f2bf(-x15); GNW[16 * 128 + (c - 128)] = (bf16)f2bf(-x16); GNW[17 * 128 + (c - 128)] = (bf16)f2bf(-x17); GNW[18 * 128 + (c - 128)] = (bf16)f2bf(-x18); GNW[19 * 128 + (c - 128)] = (bf16)f2bf(-x19); GNW[20 * 128 + (c - 128)] = (bf16)f2bf(-x20); GNW[21 * 128 + (c - 128)] = (bf16)f2bf(-x21); GNW[22 * 128 + (c - 128)] = (bf16)f2bf(-x22); GNW[23 * 128 + (c - 128)] = (bf16)f2bf(-x23); GNW[24 * 128 + (c - 128)] = (bf16)f2bf(-x24); GNW[25 * 128 + (c - 128)] = (bf16)f2bf(-x25); GNW[26 * 128 + (c - 128)] = (bf16)f2bf(-x26); GNW[27 * 128 + (c - 128)] = (bf16)f2bf(-x27); GNW[28 * 128 + (c - 128)] = (bf16)f2bf(-x28); GNW[29 * 128 + (c - 128)] = (bf16)f2bf(-x29); GNW[30 * 128 + (c - 128)] = (bf16)f2bf(-x30); GNW[31 * 128 + (c - 128)] = (bf16)f2bf(-x31); GNW[32 * 128 + (c - 128)] = (bf16)f2bf(-x32); GNW[33 * 128 + (c - 128)] = (bf16)f2bf(-x33); GNW[34 * 128 + (c - 128)] = (bf16)f2bf(-x34); GNW[35 * 128 + (c - 128)] = (bf16)f2bf(-x35); GNW[36 * 128 + (c - 128)] = (bf16)f2bf(-x36); GNW[37 * 128 + (c - 128)] = (bf16)f2bf(-x37); GNW[38 * 128 + (c - 128)] = (bf16)f2bf(-x38); GNW[39 * 128 + (c - 128)] = (bf16)f2bf(-x39); GNW[40 * 128 + (c - 128)] = (bf16)f2bf(-x40); GNW[41 * 128 + (c - 128)] = (bf16)f2bf(-x41); GNW[42 * 128 + (c - 128)] = (bf16)f2bf(-x42); GNW[43 * 128 + (c - 128)] = (bf16)f2bf(-x43); GNW[44 * 128 + (c - 128)] = (bf16)f2bf(-x44); GNW[45 * 128 + (c - 128)] = (bf16)f2bf(-x45); GNW[46 * 128 + (c - 128)] = (bf16)f2bf(-x46); GNW[47 * 128 + (c - 128)] = (bf16)f2bf(-x47); GNW[48 * 128 + (c - 128)] = (bf16)f2bf(-x48); GNW[49 * 128 + (c - 128)] = (bf16)f2bf(-x49); GNW[50 * 128 + (c - 128)] = (bf16)f2bf(-x50); GNW[51 * 128 + (c - 128)] = (bf16)f2bf(-x51); GNW[52 * 128 + (c - 128)] = (bf16)f2bf(-x52); GNW[53 * 128 + (c - 128)] = (bf16)f2bf(-x53); GNW[54 * 128 + (c - 128)] = (bf16)f2bf(-x54); GNW[55 * 128 + (c - 128)] = (bf16)f2bf(-x55); GNW[56 * 128 + (c - 128)] = (bf16)f2bf(-x56); GNW[57 * 128 + (c - 128)] = (bf16)f2bf(-x57); GNW[58 * 128 + (c - 128)] = (bf16)f2bf(-x58); GNW[59 * 128 + (c - 128)] = (bf16)f2bf(-x59); GNW[60 * 128 + (c - 128)] = (bf16)f2bf(-x60); GNW[61 * 128 + (c - 128)] = (bf16)f2bf(-x61); GNW[62 * 128 + (c - 128)] = (bf16)f2bf(-x62); GNW[63 * 128 + (c - 128)] = (bf16)f2bf(-x63); }
#undef GDN_RHS
#undef GDN_L4
    } else {
        const int t2 = tid - 256; const float gl = gcs[63];
        { const int i = t2 >> 2, d0 = (t2 & 3) * 32; const float e = __expf(gcs[i]);
#pragma unroll
          for (int x8 = 0; x8 < 4; ++x8) { const v4f a = *(const LAS v4f*)(qs + i * QP + d0 + 8 * x8), b = *(const LAS v4f*)(qs + i * QP + d0 + 8 * x8 + 4);
              v4u w; w.x = pk2(a.x * e, a.y * e); w.y = pk2(a.z * e, a.w * e); w.z = pk2(b.x * e, b.y * e); w.w = pk2(b.z * e, b.w * e); *(v4u*)(GQG + i * 128 + d0 + 8 * x8) = w; } }
        { const int d = t2 >> 1, j0 = (t2 & 1) * 32;
#pragma unroll
          for (int x8 = 0; x8 < 4; ++x8) { float o[8];
#pragma unroll
              for (int x = 0; x < 8; ++x) { const int j = j0 + 8 * x8 + x; o[x] = ks[j * QP + d] * __expf(gl - gcs[j]); }
              v4u w; w.x = pk2(o[0], o[1]); w.y = pk2(o[2], o[3]); w.z = pk2(o[4], o[5]); w.w = pk2(o[6], o[7]); *(v4u*)(GKT + d * 64 + j0 + 8 * x8) = w; } }
        if (t2 == 0) GDL[item] = __expf(gl);
    }
    __syncthreads();
}
struct GdnFrags { bf16x8_t nw[4], qg[4], at[2], kt[2][2]; float u[4]; float dl; };
__device__ __forceinline__ void gdn_load(GdnFrags& F, const Params& p, int item, int off128, int off64, int offk, int offu) {
    const bf16* GNW = (const bf16*)(p.ws + WS_GNW) + (size_t)item * 8192; const bf16* GQG = (const bf16*)(p.ws + WS_GQG) + (size_t)item * 8192;
    const bf16* GAT = (const bf16*)(p.ws + WS_GAT) + (size_t)item * 4096; const bf16* GKT = (const bf16*)(p.ws + WS_GKT) + (size_t)item * 8192; const float* GU = (const float*)(p.ws + WS_GU) + (size_t)item * 8192;
#pragma unroll
    for (int ks = 0; ks < 4; ++ks) { F.nw[ks] = *(const bf16x8_t*)(GNW + off128 + 32 * ks); F.qg[ks] = *(const bf16x8_t*)(GQG + off128 + 32 * ks); }
#pragma unroll
    for (int ks = 0; ks < 2; ++ks) { F.at[ks] = *(const bf16x8_t*)(GAT + off64 + 32 * ks); F.kt[0][ks] = *(const bf16x8_t*)(GKT + offk + 32 * ks); F.kt[1][ks] = *(const bf16x8_t*)(GKT + offk + 1024 + 32 * ks); }
#pragma unroll
    for (int r = 0; r < 4; ++r) F.u[r] = GU[offu + r * 128];
    F.dl = ((const float*)(p.ws + WS_GDL))[item];
}
constexpr int STP = 136, VNP = 72;
__device__ __forceinline__ void gdn_seq(const Params& p, LAS unsigned char* lds, int wgi, int wave, int lane) {
    const int u = wgi * 2 + (wave >> 2), wi = wave & 3, h = u >> 3, sl = u & 7, g = lane >> 4, c = lane & 15;
    LAS unsigned short* ST = (LAS unsigned short*)(lds + (wave >> 2) * 12288);
    LAS unsigned short* VNT = ST + 2 * 16 * STP;
    float* GO = (float*)(p.ws + WS_GO);
    const int off128 = (16 * wi + c) * 128 + 8 * g, off64 = (16 * wi + c) * 64 + 8 * g, offk = (32 * wi + c) * 64 + 8 * g, offu = (16 * wi + 4 * g) * 128 + 16 * sl + c;
#pragma unroll
    for (int mt = 0; mt < 2; ++mt) *(LAS v2u*)(ST + c * STP + 16 * (2 * wi + mt) + 4 * g) = (v2u){0u, 0u};
    pg8::f32x4 Sacc[2] = {{0.f, 0.f, 0.f, 0.f}, {0.f, 0.f, 0.f, 0.f}};
    __syncthreads();
    GdnFrags F0, F1;
    gdn_load(F0, p, h, off128, off64, offk, offu);
#define GDN_STEP(F, n_) do { const int cur = (n_) & 1; bf16x8_t sf[4]; \
        _Pragma("unroll") for (int ks = 0; ks < 4; ++ks) sf[ks] = *(const LAS bf16x8_t*)(ST + cur * 16 * STP + c * STP + 32 * ks + 8 * g); \
        pg8::f32x4 vn = {F.u[0], F.u[1], F.u[2], F.u[3]}; \
        _Pragma("unroll") for (int ks = 0; ks < 4; ++ks) vn = __builtin_amdgcn_mfma_f32_16x16x32_bf16(F.nw[ks], sf[ks], vn, 0, 0, 0); \
        { v2u w; w.x = pk2(vn[0], vn[1]); w.y = pk2(vn[2], vn[3]); *(LAS v2u*)(VNT + c * VNP + 16 * wi + 4 * g) = w; } \
        LDS_BAR(); \
        const bf16x8_t v0 = *(const LAS bf16x8_t*)(VNT + c * VNP + 8 * g), v1 = *(const LAS bf16x8_t*)(VNT + c * VNP + 32 + 8 * g); \
        pg8::f32x4 o = {0.f, 0.f, 0.f, 0.f}; \
        _Pragma("unroll") for (int ks = 0; ks < 4; ++ks) o = __builtin_amdgcn_mfma_f32_16x16x32_bf16(F.qg[ks], sf[ks], o, 0, 0, 0); \
        o = __builtin_amdgcn_mfma_f32_16x16x32_bf16(F.at[0], v0, o, 0, 0, 0); o = __builtin_amdgcn_mfma_f32_16x16x32_bf16(F.at[1], v1, o, 0, 0, 0); \
        { const size_t tb = (size_t)(n_) * 64 + 16 * wi + 4 * g; _Pragma("unroll") for (int r = 0; r < 4; ++r) GO[(tb + r) * BW + h * 128 + 16 * sl + c] = o[r]; } \
        _Pragma("unroll") for (int mt = 0; mt < 2; ++mt) { Sacc[mt] = Sacc[mt] * F.dl; \
            Sacc[mt] = __builtin_amdgcn_mfma_f32_16x16x32_bf16(F.kt[mt][0], v0, Sacc[mt], 0, 0, 0); Sacc[mt] = __builtin_amdgcn_mfma_f32_16x16x32_bf16(F.kt[mt][1], v1, Sacc[mt], 0, 0, 0); \
            v2u w; w.x = pk2(Sacc[mt][0], Sacc[mt][1]); w.y = pk2(Sacc[mt][2], Sacc[mt][3]); *(LAS v2u*)(ST + (cur ^ 1) * 16 * STP + c * STP + 16 * (2 * wi + mt) + 4 * g) = w; } \
        LDS_BAR(); } while (0)
    for (int n = 0; n < T / 64; n += 2) {
        gdn_load(F1, p, (n + 1) * 4 + h, off128, off64, offk, offu);
        GDN_STEP(F0, n);
        gdn_load(F0, p, ((n + 2 < T / 64) ? n + 2 : n) * 4 + h, off128, off64, offk, offu);
        GDN_STEP(F1, n + 1);
    }
#undef GDN_STEP
}

constexpr int SEQ_UOFF = 132096;
constexpr int GI_NW = 0, GI_QG = 8704, GI_AT = 17408, GI_KT = 22016, GI_SZ = 31232;
struct GdnStage { v4u r[7]; float u[4]; float dl; };
__device__ __forceinline__ void gdn_stage_load(GdnStage& Sg, const Params& p, int item, int tid, int offu) {
    const bf16* GNW = (const bf16*)(p.ws + WS_GNW) + (size_t)item * 8192; const bf16* GQG = (const bf16*)(p.ws + WS_GQG) + (size_t)item * 8192;
    const bf16* GAT = (const bf16*)(p.ws + WS_GAT) + (size_t)item * 4096; const bf16* GKT = (const bf16*)(p.ws + WS_GKT) + (size_t)item * 8192; const float* GU = (const float*)(p.ws + WS_GU) + (size_t)item * 8192;
    Sg.r[0] = *(const v4u*)(GNW + 8 * tid); Sg.r[1] = *(const v4u*)(GNW + 8 * (tid + 512)); Sg.r[2] = *(const v4u*)(GQG + 8 * tid); Sg.r[3] = *(const v4u*)(GQG + 8 * (tid + 512));
    Sg.r[4] = *(const v4u*)(GAT + 8 * tid); Sg.r[5] = *(const v4u*)(GKT + 8 * tid); Sg.r[6] = *(const v4u*)(GKT + 8 * (tid + 512));
#pragma unroll
    for (int r = 0; r < 4; ++r) Sg.u[r] = GU[offu + r * 128];
    Sg.dl = ((const float*)(p.ws + WS_GDL))[item];
}
__device__ __forceinline__ void gdn_stage_write(const GdnStage& Sg, LAS unsigned short* img, int tid) {
    { const int p0 = tid, p1 = tid + 512;
      *(LAS v4u*)(img + GI_NW + (p0 >> 4) * 136 + 8 * (p0 & 15)) = Sg.r[0]; *(LAS v4u*)(img + GI_NW + (p1 >> 4) * 136 + 8 * (p1 & 15)) = Sg.r[1];
      *(LAS v4u*)(img + GI_QG + (p0 >> 4) * 136 + 8 * (p0 & 15)) = Sg.r[2]; *(LAS v4u*)(img + GI_QG + (p1 >> 4) * 136 + 8 * (p1 & 15)) = Sg.r[3];
      *(LAS v4u*)(img + GI_AT + (p0 >> 3) * 72 + 8 * (p0 & 7)) = Sg.r[4];
      *(LAS v4u*)(img + GI_KT + (p0 >> 3) * 72 + 8 * (p0 & 7)) = Sg.r[5]; *(LAS v4u*)(img + GI_KT + (p1 >> 3) * 72 + 8 * (p1 & 7)) = Sg.r[6]; }
}
__device__ __forceinline__ void gdn_seq2(const Params& p, LAS unsigned char* lds, int wgi, int tid, int wave, int lane) {
    const int h = wgi >> 2, sl = 2 * (wgi & 3) + (wave >> 2), wi = wave & 3, g = lane >> 4, c = lane & 15;
    LAS unsigned short* IMG = (LAS unsigned short*)lds;
    LAS unsigned short* ST = (LAS unsigned short*)(lds + SEQ_UOFF + (wave >> 2) * 12288);
    LAS unsigned short* VNT = ST + 2 * 16 * STP;
    float* GO = (float*)(p.ws + WS_GO);
    const int offu = (16 * wi + 4 * g) * 128 + 16 * sl + c;
#pragma unroll
    for (int mt = 0; mt < 2; ++mt) *(LAS v2u*)(ST + c * STP + 16 * (2 * wi + mt) + 4 * g) = (v2u){0u, 0u};
    pg8::f32x4 Sacc[2] = {{0.f, 0.f, 0.f, 0.f}, {0.f, 0.f, 0.f, 0.f}};
    GdnStage A, B;
    gdn_stage_load(A, p, h, tid, offu); gdn_stage_write(A, IMG, tid);
    gdn_stage_load(B, p, 4 + h, tid, offu);
    LDS_BAR();
    constexpr int NCH = T / 64;
#define GDN_STEP2(X, Y, n_) do { const int cur = (n_) & 1; const LAS unsigned short* im = IMG + cur * GI_SZ; bf16x8_t sf[4]; \
        _Pragma("unroll") for (int ks = 0; ks < 4; ++ks) sf[ks] = *(const LAS bf16x8_t*)(ST + cur * 16 * STP + c * STP + 32 * ks + 8 * g); \
        pg8::f32x4 vn = {X.u[0], X.u[1], X.u[2], X.u[3]}; const float dl = X.dl; \
        _Pragma("unroll") for (int ks = 0; ks < 4; ++ks) vn = __builtin_amdgcn_mfma_f32_16x16x32_bf16(*(const LAS bf16x8_t*)(im + GI_NW + (16 * wi + c) * 136 + 32 * ks + 8 * g), sf[ks], vn, 0, 0, 0); \
        { v2u w; w.x = pk2(vn[0], vn[1]); w.y = pk2(vn[2], vn[3]); *(LAS v2u*)(VNT + c * VNP + 16 * wi + 4 * g) = w; } \
        pg8::f32x4 o = {0.f, 0.f, 0.f, 0.f}; \
        _Pragma("unroll") for (int ks = 0; ks < 4; ++ks) o = __builtin_amdgcn_mfma_f32_16x16x32_bf16(*(const LAS bf16x8_t*)(im + GI_QG + (16 * wi + c) * 136 + 32 * ks + 8 * g), sf[ks], o, 0, 0, 0); \
        LDS_BAR(); \
        gdn_stage_load(X, p, (((n_) + 2 < NCH) ? (n_) + 2 : (n_)) * 4 + h, tid, offu); \
        const bf16x8_t v0 = *(const LAS bf16x8_t*)(VNT + c * VNP + 8 * g), v1 = *(const LAS bf16x8_t*)(VNT + c * VNP + 32 + 8 * g); \
        o = __builtin_amdgcn_mfma_f32_16x16x32_bf16(*(const LAS bf16x8_t*)(im + GI_AT + (16 * wi + c) * 72 + 8 * g), v0, o, 0, 0, 0); \
        o = __builtin_amdgcn_mfma_f32_16x16x32_bf16(*(const LAS bf16x8_t*)(im + GI_AT + (16 * wi + c) * 72 + 32 + 8 * g), v1, o, 0, 0, 0); \
        { const size_t tb = (size_t)(n_) * 64 + 16 * wi + 4 * g; _Pragma("unroll") for (int r = 0; r < 4; ++r) GO[(tb + r) * BW + h * 128 + 16 * sl + c] = o[r]; } \
        _Pragma("unroll") for (int mt = 0; mt < 2; ++mt) { Sacc[mt] = Sacc[mt] * dl; \
            Sacc[mt] = __builtin_amdgcn_mfma_f32_16x16x32_bf16(*(const LAS bf16x8_t*)(im + GI_KT + (16 * (2 * wi + mt) + c) * 72 + 8 * g), v0, Sacc[mt], 0, 0, 0); \
            Sacc[mt] = __builtin_amdgcn_mfma_f32_16x16x32_bf16(*(const LAS bf16x8_t*)(im + GI_KT + (16 * (2 * wi + mt) + c) * 72 + 32 + 8 * g), v1, Sacc[mt], 0, 0, 0); \
            v2u w; w.x = pk2(Sacc[mt][0], Sacc[mt][1]); w.y = pk2(Sacc[mt][2], Sacc[mt][3]); *(LAS v2u*)(ST + (cur ^ 1) * 16 * STP + c * STP + 16 * (2 * wi + mt) + 4 * g) = w; } \
        gdn_stage_write(Y, IMG + (cur ^ 1) * GI_SZ, tid); \
        LDS_BAR(); } while (0)
    for (int n = 0; n < NCH; n += 2) { GDN_STEP2(A, B, n); GDN_STEP2(B, A, n + 1); }
#undef GDN_STEP2
}
constexpr int MI_Q = 0, MI_S = 4608, MI_K = 9216, MI_SZ = 13824;
struct MlStage { v4u r[3]; bf16x8_t vt[2]; float fl; };
__device__ __forceinline__ void ml_stage_load(MlStage& Sg, const Params& p, int item, int tid, int offV) {
    const bf16* MQ = (const bf16*)(p.ws + WS_MQ) + (size_t)item * 4096; const bf16* MS = (const bf16*)(p.ws + WS_MS) + (size_t)item * 4096; const bf16* MK = (const bf16*)(p.ws + WS_MK) + (size_t)item * 4096;
    const bf16* MV = (const bf16*)(p.ws + WS_MV) + (size_t)item * 9216;
    Sg.r[0] = *(const v4u*)(MQ + 8 * tid); Sg.r[1] = *(const v4u*)(MS + 8 * tid); Sg.r[2] = *(const v4u*)(MK + 8 * tid);
    Sg.vt[0] = *(const bf16x8_t*)(MV + offV); Sg.vt[1] = *(const bf16x8_t*)(MV + offV + 32);
    Sg.fl = ((const float*)(p.ws + WS_MFL))[item];
}
__device__ __forceinline__ void ml_stage_write(const MlStage& Sg, LAS unsigned short* img, int tid) {
    const int o = (tid >> 3) * 72 + 8 * (tid & 7);
    *(LAS v4u*)(img + MI_Q + o) = Sg.r[0]; *(LAS v4u*)(img + MI_S + o) = Sg.r[1]; *(LAS v4u*)(img + MI_K + o) = Sg.r[2];
}
__device__ __forceinline__ void ml_seq2(const Params& p, LAS unsigned char* lds, int wgi, int tid, int wave, int lane) {
    const int h = wgi / 5, sl0 = 2 * (wgi % 5) + (wave >> 2), wi = wave & 3, g = lane >> 4, c = lane & 15;
    const bool real = sl0 < 9; const int sl = real ? sl0 : 8;
    LAS unsigned short* IMG = (LAS unsigned short*)lds;
    LAS unsigned short* CT = (LAS unsigned short*)(lds + SEQ_UOFF + (wave >> 2) * 8192);
    float* HO = (float*)(p.ws + WS_HO); float* HDEN = (float*)(p.ws + WS_HDEN);
    const int offV = (16 * sl + c) * 64 + 8 * g;
    *(LAS v2u*)(CT + c * 72 + 16 * wi + 4 * g) = (v2u){0u, 0u};
    pg8::f32x4 Cacc = {0.f, 0.f, 0.f, 0.f};
    MlStage A, B;
    ml_stage_load(A, p, h, tid, offV); ml_stage_write(A, IMG, tid);
    ml_stage_load(B, p, 4 + h, tid, offV);
    LDS_BAR();
    constexpr int NCH = T / 64;
#define ML_STEP2(X, Y, n_) do { const int cur = (n_) & 1; const LAS unsigned short* im = IMG + cur * MI_SZ; const int ro = (16 * wi + c) * 72 + 8 * g; \
        const bf16x8_t c0 = *(const LAS bf16x8_t*)(CT + cur * 16 * 72 + c * 72 + 8 * g), c1 = *(const LAS bf16x8_t*)(CT + cur * 16 * 72 + c * 72 + 32 + 8 * g); \
        const bf16x8_t vt0 = X.vt[0], vt1 = X.vt[1]; const float fl = X.fl; \
        pg8::f32x4 num = {0.f, 0.f, 0.f, 0.f}; \
        num = __builtin_amdgcn_mfma_f32_16x16x32_bf16(*(const LAS bf16x8_t*)(im + MI_Q + ro), c0, num, 0, 0, 0); num = __builtin_amdgcn_mfma_f32_16x16x32_bf16(*(const LAS bf16x8_t*)(im + MI_Q + ro + 32), c1, num, 0, 0, 0); \
        num = __builtin_amdgcn_mfma_f32_16x16x32_bf16(*(const LAS bf16x8_t*)(im + MI_S + ro), vt0, num, 0, 0, 0); num = __builtin_amdgcn_mfma_f32_16x16x32_bf16(*(const LAS bf16x8_t*)(im + MI_S + ro + 32), vt1, num, 0, 0, 0); \
        Cacc = Cacc * fl; \
        Cacc = __builtin_amdgcn_mfma_f32_16x16x32_bf16(*(const LAS bf16x8_t*)(im + MI_K + ro), vt0, Cacc, 0, 0, 0); Cacc = __builtin_amdgcn_mfma_f32_16x16x32_bf16(*(const LAS bf16x8_t*)(im + MI_K + ro + 32), vt1, Cacc, 0, 0, 0); \
        ml_stage_load(X, p, (((n_) + 2 < NCH) ? (n_) + 2 : (n_)) * 4 + h, tid, offV); \
        { v2u w; w.x = pk2(Cacc[0], Cacc[1]); w.y = pk2(Cacc[2], Cacc[3]); *(LAS v2u*)(CT + (cur ^ 1) * 16 * 72 + c * 72 + 16 * wi + 4 * g) = w; } \
        { const size_t tb = (size_t)(n_) * 64 + 16 * wi + 4 * g; \
          if (sl < 8) { _Pragma("unroll") for (int r = 0; r < 4; ++r) HO[(tb + r) * BW + h * 128 + 16 * sl + c] = num[r]; } \
          else if (c == 0 && real) { _Pragma("unroll") for (int r = 0; r < 4; ++r) HDEN[(tb + r) * 4 + h] = num[r]; } } \
        ml_stage_write(Y, IMG + (cur ^ 1) * MI_SZ, tid); \
        LDS_BAR(); } while (0)
    for (int n = 0; n < NCH; n += 2) { ML_STEP2(A, B, n); ML_STEP2(B, A, n + 1); }
#undef ML_STEP2
}

__device__ __forceinline__ void mixer_gmlp_item(const Params& p, int l, LAS unsigned char* lds, int item, int tid, int wave, int lane) {
    const int chunk = item >> 2, g = item & 3; const size_t tok0 = (size_t)chunk * 128;
    const bf16* Z = (const bf16*)(p.ws + WS_Z); bf16* BR1 = (bf16*)(p.ws + WS_BR) + 1 * BW;
    const float* ng = p.in[I_GMNG] + l * BW; const float* nb = p.in[I_GMNB] + l * BW;
    const float* wsp = p.in[I_GMWS] + ((size_t)(l * 4 + g) * 128) * 128; const float* bsp = p.in[I_GMBS] + (l * 4 + g) * 128;
    LAS float* vn = (LAS float*)lds;
    for (int r = 0; r < 16; ++r) { const int tk = wave * 16 + r;
        const v4u raw = *(const v4u*)(Z + (tok0 + tk) * ZC + ZC_GMV + 8 * lane); float x[8]; unpack8(raw, x); float s = 0.f;
#pragma unroll
        for (int i = 0; i < 8; ++i) { x[i] = gelu_tanh(x[i]); s += x[i]; }
        const float mean = wave_sum(s) * (1.f / 512.f); float ss = 0.f;
#pragma unroll
        for (int i = 0; i < 8; ++i) { x[i] -= mean; ss += x[i] * x[i]; }
        const float rstd = rsqrtf(wave_sum(ss) * (1.f / 512.f) + LN_EPS);
        if ((lane >> 4) == g) { const int cl = 8 * (lane & 15);
#pragma unroll
            for (int i = 0; i < 8; ++i) vn[tk * 128 + cl + i] = x[i] * rstd * ng[8 * lane + i] + nb[8 * lane + i]; }
    }
    __syncthreads();
    const int t = tid >> 2, cq = tid & 3; float acc[32];
#pragma unroll
    for (int i = 0; i < 32; ++i) acc[i] = 0.f;
    const float* wrow = wsp + (size_t)t * 128;
    for (int s = 0; s <= t; ++s) { const float w = wrow[s]; const LAS float* row = vn + s * 128 + cq * 32;
#pragma unroll
        for (int i4 = 0; i4 < 8; ++i4) { const v4f a = *(const LAS v4f*)(row + 4 * i4); acc[4 * i4] += w * a.x; acc[4 * i4 + 1] += w * a.y; acc[4 * i4 + 2] += w * a.z; acc[4 * i4 + 3] += w * a.w; } }
    const float bias = bsp[t];
#pragma unroll
    for (int i8 = 0; i8 < 4; ++i8) { const v4u raw = *(const v4u*)(Z + (tok0 + t) * ZC + ZC_GMU + g * 128 + cq * 32 + 8 * i8); float u[8]; unpack8(raw, u); float o[8];
#pragma unroll
        for (int i = 0; i < 8; ++i) o[i] = gelu_tanh(u[i]) * (acc[8 * i8 + i] + bias);
#if MERGE_FP8
        *(v2u*)((unsigned char*)(p.ws + WS_BR) + (tok0 + t) * BRW + 1 * BW + g * 128 + cq * 32 + 8 * i8) = (v2u){pk4_f8(o[0], o[1], o[2], o[3], BRSC), pk4_f8(o[4], o[5], o[6], o[7], BRSC)}; }
#else
        v4u w; w.x = pk2(o[0], o[1]); w.y = pk2(o[2], o[3]); w.z = pk2(o[4], o[5]); w.w = pk2(o[6], o[7]);
        *(v4u*)(BR1 + (tok0 + t) * BRW + g * 128 + cq * 32 + 8 * i8) = w; }
#endif
    __syncthreads();
}

__device__ __forceinline__ void vt_item(const Params& p, LAS unsigned char* lds, int item, int tid) {
    const int h = item & 3, n = item >> 2; const size_t t0 = (size_t)n * 64;
    const bf16* Z = (const bf16*)(p.ws + WS_Z); bf16* VT = (bf16*)(p.ws + WS_VT);
    LAS unsigned short* vs = (LAS unsigned short*)lds;
#pragma unroll
    for (int r = 0; r < 2; ++r) { const int idx = tid + 512 * r, tk = idx >> 4, c8 = idx & 15;
        *(LAS v4u*)(vs + tk * 136 + 8 * c8) = *(const v4u*)(Z + (t0 + tk) * ZC + ZC_SBV + h * 128 + 8 * c8); }
    __syncthreads();
    { const int d = tid >> 2, jq = tid & 3; unsigned w[8];
#pragma unroll
      for (int x = 0; x < 8; ++x) w[x] = (unsigned)vs[(16 * jq + 2 * x) * 136 + d] | ((unsigned)vs[(16 * jq + 2 * x + 1) * 136 + d] << 16);
      bf16* dst = VT + ((size_t)h * 128 + d) * T + t0 + 16 * jq;
      *(v4u*)dst = (v4u){w[0], w[1], w[2], w[3]}; *(v4u*)(dst + 8) = (v4u){w[4], w[5], w[6], w[7]}; }
    __syncthreads();
}
constexpr int KTP = 136, VTP = 72;
__device__ __forceinline__ void sb_unit(const Params& p, LAS unsigned char* lds, int unit, int tid, int wave, int lane) {
    const int h = unit >> 6, q0 = (unit & 63) * 128, g = lane >> 4, c = lane & 15; const int qrow = q0 + 16 * wave + c;
    const bf16* Z = (const bf16*)(p.ws + WS_Z); const bf16* VT = (const bf16*)(p.ws + WS_VT) + (size_t)h * 128 * T; bf16* BR0 = (bf16*)(p.ws + WS_BR);
    LAS unsigned short* Kt = (LAS unsigned short*)lds;
    LAS unsigned short* Vt = Kt + 2 * 64 * KTP;
    LAS int* flags = (LAS int*)(Vt + 2 * 128 * VTP);
    bf16x8_t qf[4];
#pragma unroll
    for (int ks = 0; ks < 4; ++ks) qf[ks] = *(const bf16x8_t*)(Z + (size_t)qrow * ZC + ZC_SBQ + h * 128 + 32 * ks + 8 * g);
    pg8::f32x4 acc[8];
#pragma unroll
    for (int dt = 0; dt < 8; ++dt) acc[dt] = (pg8::f32x4){0.f, 0.f, 0.f, 0.f};
    float racc = 0.f;
    v4u kr[2], vr[2];
    const int jt = (q0 >> 6) + 1;
#define SB_GLOAD(j_) do { _Pragma("unroll") for (int r = 0; r < 2; ++r) { const int idx = tid + 512 * r; \
        kr[r] = *(const v4u*)(Z + (size_t)(64 * (j_) + (idx >> 4)) * ZC + ZC_SBK + h * 128 + 8 * (idx & 15)); \
        vr[r] = *(const v4u*)(VT + (size_t)(idx >> 3) * T + 64 * (j_) + 8 * (idx & 7)); } } while (0)
#define SB_LWRITE(b_) do { _Pragma("unroll") for (int r = 0; r < 2; ++r) { const int idx = tid + 512 * r; \
        *(LAS v4u*)(Kt + (b_) * 64 * KTP + (idx >> 4) * KTP + 8 * (idx & 15)) = kr[r]; *(LAS v4u*)(Vt + (b_) * 128 * VTP + (idx >> 3) * VTP + 8 * (idx & 7)) = vr[r]; } } while (0)
    LDS_BAR();
    SB_GLOAD(jt); SB_LWRITE(0);
    LDS_BAR();
    for (int j = jt, it = 0; j >= 0; --j, ++it) {
        const int cur = it & 1;
        SB_GLOAD(j > 0 ? j - 1 : 0);
        const bool wdone = __all(racc > 104.f);
        if (64 * j < q0 + 16 * wave + 15 && !wdone) {
            const LAS unsigned short* Kc = Kt + cur * 64 * KTP; const LAS unsigned short* Vc = Vt + cur * 128 * VTP;
            pg8::f32x4 z[4];
#pragma unroll
            for (int s = 0; s < 4; ++s) { z[s] = (pg8::f32x4){0.f, 0.f, 0.f, 0.f};
#pragma unroll
                for (int ks = 0; ks < 4; ++ks) z[s] = __builtin_amdgcn_mfma_f32_16x16x32_bf16(*(const LAS bf16x8_t*)(Kc + (16 * s + c) * KTP + 32 * ks + 8 * g), qf[ks], z[s], 0, 0, 0); }
            float sp[4][4], t[4], xs[4]; bool mk[4][4];
#pragma unroll
            for (int s = 0; s < 4; ++s) { t[s] = 0.f;
#pragma unroll
                for (int r = 0; r < 4; ++r) { const int key = 64 * j + 16 * s + 4 * g + r; mk[s][r] = key < qrow; const float zz = z[s][r] * 0.08838834764831845f; z[s][r] = zz;
                    sp[s][r] = mk[s][r] ? softplusf_(zz) : 0.f; t[s] += sp[s][r]; } }
            float grand = 0.f, higher[4];
#pragma unroll
            for (int s = 3; s >= 0; --s) { float x = t[s]; float y = __shfl(x, lane + 16); x += (g < 3) ? y : 0.f; y = __shfl(x, lane + 32); x += (g < 2) ? y : 0.f;
                xs[s] = x - t[s];
                const float tot = __shfl(x, c); higher[s] = grand; grand += tot; }
            bf16x8_t pf[2];
#pragma unroll
            for (int s = 0; s < 4; ++s) { float a[4]; float e = 0.f;
#pragma unroll
                for (int r = 3; r >= 0; --r) { const float la = z[s][r] - sp[s][r] - (racc + higher[s] + xs[s] + e); a[r] = mk[s][r] ? __expf(la) : 0.f; e += sp[s][r]; }
                const unsigned w0 = pk2(a[0], a[1]), w1 = pk2(a[2], a[3]);
                if ((s & 1) == 0) { pf[s >> 1][0] = (short)(w0 & 0xffff); pf[s >> 1][1] = (short)(w0 >> 16); pf[s >> 1][2] = (short)(w1 & 0xffff); pf[s >> 1][3] = (short)(w1 >> 16); }
                else              { pf[s >> 1][4] = (short)(w0 & 0xffff); pf[s >> 1][5] = (short)(w0 >> 16); pf[s >> 1][6] = (short)(w1 & 0xffff); pf[s >> 1][7] = (short)(w1 >> 16); } }
            racc += grand;
#pragma unroll
            for (int dt = 0; dt < 8; ++dt)
#pragma unroll
                for (int k2 = 0; k2 < 2; ++k2) { const v2u lo = *(const LAS v2u*)(Vc + (16 * dt + c) * VTP + 32 * k2 + 4 * g), hi = *(const LAS v2u*)(Vc + (16 * dt + c) * VTP + 32 * k2 + 16 + 4 * g);
                    const v4u vv = (v4u){lo.x, lo.y, hi.x, hi.y};
                    acc[dt] = __builtin_amdgcn_mfma_f32_16x16x32_bf16(__builtin_bit_cast(bf16x8_t, vv), pf[k2], acc[dt], 0, 0, 0); }
        }
        const bool wd2 = __all(racc > 104.f);
        if (lane == 0) flags[cur * 8 + wave] = wd2 ? 1 : 0;
        SB_LWRITE(cur ^ 1);
        LDS_BAR();
        int alld = 1;
#pragma unroll
        for (int w = 0; w < 8; ++w) alld &= flags[cur * 8 + w];
        if (alld) break;
    }
#undef SB_GLOAD
#undef SB_LWRITE
#pragma unroll
#if MERGE_FP8
    for (int dt = 0; dt < 8; ++dt) *(unsigned*)((unsigned char*)BR0 + (size_t)qrow * BRW + h * 128 + 16 * dt + 4 * g) = pk4_f8(acc[dt][0], acc[dt][1], acc[dt][2], acc[dt][3], BRSC);
#else
    for (int dt = 0; dt < 8; ++dt) { v2u w; w.x = pk2(acc[dt][0], acc[dt][1]); w.y = pk2(acc[dt][2], acc[dt][3]); *(v2u*)(BR0 + (size_t)qrow * BRW + h * 128 + 16 * dt + 4 * g) = w; }
#endif
}

__device__ __forceinline__ void phase_mixers(const Params& p, int l, LAS unsigned char* lds, int wg, int G, int tid, int wave, int lane, const XcdBarrier& bar) {
#if defined(PROBE_SPLIT)
    if (wg < 16) gdn_seq2(p, lds, wg, tid, wave, lane); else if (wg < 36) ml_seq2(p, lds, wg - 16, tid, wave, lane);
    xcd_barrier(bar);
    const int w2 = wg, G2 = G;
#else
    if (wg < 16) { gdn_seq2(p, lds, wg, tid, wave, lane); return; }
    if (wg < 36) { ml_seq2(p, lds, wg - 16, tid, wave, lane); return; }
    const int w2 = wg - 36, G2 = G - 36;
#endif
    for (int it = w2; it < 256; it += G2) mixer_gmlp_item(p, l, lds, it, tid, wave, lane);
    for (int it = w2; it < 256; it += G2) sb_unit(p, lds, it, tid, wave, lane);
#if !defined(PROBE_CONV0)
    __syncthreads();
#if defined(PROBE_CONVDUP)
#pragma nounroll
    for (int rep = 0; rep < 2; ++rep)
#endif
    phase_convert<1>(p, l, lds, w2 * 8 + wave, G2 * 8, wave, lane
#if defined(PROBE_CONVDUP)
        , (PROBE_CONVDUP == 2) && rep == 1
#endif
        );
#endif
}

__device__ __forceinline__ void phase_post(const Params& p, int l, int gw, int NGW, int lane) {
    const bf16* Z = (const bf16*)(p.ws + WS_Z); const float* GO = (const float*)(p.ws + WS_GO); const float* HO = (const float*)(p.ws + WS_HO); const float* HDEN = (const float*)(p.ws + WS_HDEN);
    bf16* BR2 = (bf16*)(p.ws + WS_BR) + 2 * BW; bf16* BR3 = (bf16*)(p.ws + WS_BR) + 3 * BW;
    const float* gng = p.in[I_GDNNG] + l * 128; const float* mng = p.in[I_MLNG] + l * BW;
    for (int t = gw; t < T; t += NGW) {
        {   const v4f a0 = *(const v4f*)(GO + (size_t)t * BW + 8 * lane), a1 = *(const v4f*)(GO + (size_t)t * BW + 8 * lane + 4); float o[8] = {a0.x, a0.y, a0.z, a0.w, a1.x, a1.y, a1.z, a1.w}; float ss = 0.f;
#pragma unroll
            for (int i = 0; i < 8; ++i) ss += o[i] * o[i];
            const float r = rsqrtf(sum16(ss) * (1.f / 128.f) + LN_EPS);
            const v4u graw = *(const v4u*)(Z + (size_t)t * ZC + ZC_GDNG + 8 * lane); float gt[8]; unpack8(graw, gt);
#pragma unroll
            for (int i = 0; i < 8; ++i) o[i] = o[i] * r * gng[(8 * lane + i) & 127] * siluf_(gt[i]);
#if MERGE_FP8
            *(v2u*)((unsigned char*)(p.ws + WS_BR) + (size_t)t * BRW + 2 * BW + 8 * lane) = (v2u){pk4_f8(o[0], o[1], o[2], o[3], BRSC), pk4_f8(o[4], o[5], o[6], o[7], BRSC)}; }
#else
            v4u w; w.x = pk2(o[0], o[1]); w.y = pk2(o[2], o[3]); w.z = pk2(o[4], o[5]); w.w = pk2(o[6], o[7]); *(v4u*)(BR2 + (size_t)t * BRW + 8 * lane) = w; }
#endif
        {   const v4f a0 = *(const v4f*)(HO + (size_t)t * BW + 8 * lane), a1 = *(const v4f*)(HO + (size_t)t * BW + 8 * lane + 4); float o[8] = {a0.x, a0.y, a0.z, a0.w, a1.x, a1.y, a1.z, a1.w}; float ss = 0.f;
            const float dn = 1.f / fmaxf(fabsf(HDEN[(size_t)t * 4 + (lane >> 4)]), 1.f);
#pragma unroll
            for (int i = 0; i < 8; ++i) { o[i] *= dn; ss += o[i] * o[i]; }
            const float r = rsqrtf(sum16(ss) * (1.f / 128.f) + LN_EPS);
            const v4u graw = *(const v4u*)(Z + (size_t)t * ZC + ZC_MLO + 8 * lane); float gt[8]; unpack8(graw, gt);
#pragma unroll
            for (int i = 0; i < 8; ++i) o[i] = o[i] * r * mng[8 * lane + i] * sigmoidf_(gt[i]);
#if MERGE_FP8
            *(v2u*)((unsigned char*)(p.ws + WS_BR) + (size_t)t * BRW + 3 * BW + 8 * lane) = (v2u){pk4_f8(o[0], o[1], o[2], o[3], BRSC), pk4_f8(o[4], o[5], o[6], o[7], BRSC)}; }
#else
            v4u w; w.x = pk2(o[0], o[1]); w.y = pk2(o[2], o[3]); w.z = pk2(o[4], o[5]); w.w = pk2(o[6], o[7]); *(v4u*)(BR3 + (size_t)t * BRW + 8 * lane) = w; }
#endif
    }
}

__device__ __forceinline__ void ln_row(const float* yrow, const float* g, const float* b, int lane, v4f (&v)[8]) {
    const v4f* yr = (const v4f*)yrow + lane; float s = 0.f;
#pragma unroll
    for (int j = 0; j < 8; ++j) { v[j] = yr[64 * j]; s += (v[j].x + v[j].y) + (v[j].z + v[j].w); }
    const float mean = wave_sum(s) * (1.f / D); float s2 = 0.f;
#pragma unroll
    for (int j = 0; j < 8; ++j) { v[j] = v[j] - mean; s2 += (v[j].x * v[j].x + v[j].y * v[j].y) + (v[j].z * v[j].z + v[j].w * v[j].w); }
    const float rstd = rsqrtf(wave_sum(s2) * (1.f / D) + LN_EPS);
#pragma unroll
    for (int j = 0; j < 8; ++j) { const v4f gg = ((const v4f*)g)[lane + 64 * j], bb = ((const v4f*)b)[lane + 64 * j]; v[j] = v[j] * rstd * gg + bb; }
}
constexpr int RT_XP = 2052;
constexpr int RT_TAB = 131072 + 1024;
__device__ __forceinline__ void phase_ln1_router(const Params& p, int l, LAS unsigned char* lds, int wg, int G, int wave, int lane, int cnt_shift = 0) {
    const bf16* Y = (const bf16*)(p.ws + WS_Y); bf16* X1 = (bf16*)(p.ws + WS_X1); bf16* X1B = (bf16*)(p.ws + WS_X1B); int* LIST = (int*)(p.ws + WS_LIST); float* WL = (float*)(p.ws + WS_WL); unsigned* SLOT = (unsigned*)(p.ws + WS_SLOT);
    unsigned* cnt = (unsigned*)(p.ws + WS_CTL) + CW_CNT + l * 4096 + cnt_shift;
    const float* g1 = p.in[I_LN1G] + (size_t)l * D; const float* b1 = p.in[I_LN1B] + (size_t)l * D;
    const float* wr = p.in[I_WR] + (size_t)l * D * NE; const float rbias = p.in[I_RB][l * NE + lane];
    LAS float* xt = (LAS float*)lds;
    LAS float* part = (LAS float*)lds;
    LAS unsigned char* selm = lds + RT_TAB; LAS unsigned char* rkm = selm + 4096; LAS float* wtm = (LAS float*)(rkm + 4096); LAS unsigned* basem = (LAS unsigned*)(wtm + 4096);
    const int n_l = lane & 15, kq = lane >> 4;
    int gi = 0;
    for (int tg = wg; tg < T / 16; tg += G, ++gi) {
        {   v4f va[8], vb[8]; const size_t m0 = (size_t)tg * 16 + 2 * wave;
#pragma unroll
            for (int j = 0; j < 8; ++j) { va[j] = ld4(Y, m0 * D + 4 * lane + 256 * j, true); vb[j] = ld4(Y, (m0 + 1) * D + 4 * lane + 256 * j, true); }
            float sa = 0.f, sb = 0.f;
#pragma unroll
            for (int j = 0; j < 8; ++j) { sa += (va[j].x + va[j].y) + (va[j].z + va[j].w); sb += (vb[j].x + vb[j].y) + (vb[j].z + vb[j].w); }
            const float ma = wave_sum(sa) * (1.f / D), mb = wave_sum(sb) * (1.f / D); float qa = 0.f, qb = 0.f;
#pragma unroll
            for (int j = 0; j < 8; ++j) { va[j] = va[j] - ma; vb[j] = vb[j] - mb; qa += (va[j].x * va[j].x + va[j].y * va[j].y) + (va[j].z * va[j].z + va[j].w * va[j].w); qb += (vb[j].x * vb[j].x + vb[j].y * vb[j].y) + (vb[j].z * vb[j].z + vb[j].w * vb[j].w); }
            const float ra = rsqrtf(wave_sum(qa) * (1.f / D) + LN_EPS), rb = rsqrtf(wave_sum(qb) * (1.f / D) + LN_EPS);
#pragma unroll
            for (int j = 0; j < 8; ++j) { const v4f gg = ((const v4f*)g1)[lane + 64 * j], bb = ((const v4f*)b1)[lane + 64 * j]; va[j] = va[j] * ra * gg + bb; vb[j] = vb[j] * rb * gg + bb; }
#pragma unroll
            for (int rr = 0; rr < 2; ++rr) { const size_t m = m0 + rr; v2u* xo = (v2u*)(X1 + m * D) + lane;
#pragma unroll
                for (int j = 0; j < 8; ++j) { const v4f v = rr ? vb[j] : va[j]; xo[64 * j] = (v2u){pk2(v.x, v.y), pk2(v.z, v.w)};
#if MOE_UP_FP8
                    { unsigned w = 0; w = __builtin_amdgcn_cvt_pk_fp8_f32(v.x, v.y, w, false); w = __builtin_amdgcn_cvt_pk_fp8_f32(v.z, v.w, w, true); ((unsigned*)((unsigned char*)X1B + m * D))[lane + 64 * j] = w; }
#else
                    { v2u o; o.x = pk2(v.x, v.y); o.y = pk2(v.z, v.w); ((v2u*)(X1B + m * D))[lane + 64 * j] = o; }
#endif
                    *(LAS v4f*)(xt + (2 * wave + rr) * RT_XP + 4 * lane + 256 * j) = v; } } }
        __syncthreads();
        {   pg8::f32x4 acc[4];
#pragma unroll
            for (int i = 0; i < 4; ++i) acc[i] = (pg8::f32x4){0.f, 0.f, 0.f, 0.f};
            const float* wb = wr + (size_t)(256 * wave + 4 * kq) * NE + 4 * n_l;
            const LAS float* xa = xt + n_l * RT_XP + 256 * wave + 4 * kq;
            v4f bwa[16], bwb[16];
#define RT_LOADW(dst, sb_) do { _Pragma("unroll") for (int q = 0; q < 16; ++q) dst[q] = *(const v4f*)(wb + (size_t)(16 * (4 * (sb_) + (q >> 2)) + (q & 3)) * NE); } while (0)
#define RT_MMA(src, sb_) do { _Pragma("unroll") for (int sg = 0; sg < 4; ++sg) { const v4f a4 = *(const LAS v4f*)(xa + 16 * (4 * (sb_) + sg)); \
                _Pragma("unroll") for (int c = 0; c < 4; ++c) { const v4f b4 = src[sg * 4 + c]; const float a = c == 0 ? a4.x : c == 1 ? a4.y : c == 2 ? a4.z : a4.w; \
                    acc[0] = __builtin_amdgcn_mfma_f32_16x16x4f32(a, b4.x, acc[0], 0, 0, 0); acc[1] = __builtin_amdgcn_mfma_f32_16x16x4f32(a, b4.y, acc[1], 0, 0, 0); \
                    acc[2] = __builtin_amdgcn_mfma_f32_16x16x4f32(a, b4.z, acc[2], 0, 0, 0); acc[3] = __builtin_amdgcn_mfma_f32_16x16x4f32(a, b4.w, acc[3], 0, 0, 0); } } } while (0)
            RT_LOADW(bwa, 0);
#pragma unroll 1
            for (int h = 0; h < 2; ++h) {
                RT_LOADW(bwb, 1); RT_MMA(bwa, 0);
                if (h == 0) RT_LOADW(bwa, 2);
                RT_MMA(bwb, 1);
                wb += (size_t)128 * NE; xa += 128; asm volatile("" : "+v"(wb));
            }
#undef RT_LOADW
#undef RT_MMA
            __syncthreads();
#pragma unroll
            for (int j = 0; j < 4; ++j) *(LAS v4f*)(part + (wave * 16 + 4 * kq + j) * 64 + 4 * n_l) = (v4f){acc[0][j], acc[1][j], acc[2][j], acc[3][j]}; }
        __syncthreads();
#pragma unroll 1
        for (int rr = 0; rr < 2; ++rr) { const int lr = wave + 8 * rr; float logit = 0.f;
#pragma unroll
            for (int w = 0; w < 8; ++w) logit += part[(w * 16 + lr) * 64 + lane];
            const float s = sigmoidf_(logit), biased = s + rbias;
            const float m1 = max8(biased); const float li = (float)(lane & 7);
            const float first = min8(biased == m1 ? li : 8.f);
            const float m2 = max8(li == first ? -INFINITY : biased);
            const float gs = m1 + m2; const int myg = lane >> 3; int grank = 0;
#pragma unroll
            for (int g2 = 0; g2 < 8; ++g2) { const float o = __builtin_bit_cast(float, __builtin_amdgcn_readlane(__builtin_bit_cast(int, gs), g2 * 8)); grank += (o > gs || (o == gs && g2 < myg)) ? 1 : 0; }
            const float masked = grank < 4 ? biased : -INFINITY; int rank = 0;
#pragma unroll
            for (int e2 = 0; e2 < 64; ++e2) { const float o = __builtin_bit_cast(float, __builtin_amdgcn_readlane(__builtin_bit_cast(int, masked), e2)); rank += (o > masked || (o == masked && e2 < lane)) ? 1 : 0; }
            const float wsel = rank < 6 ? s : 0.f; const float tot = wave_sum(wsel);
            const int ri = gi * 16 + lr;
            selm[ri * 64 + lane] = (rank < 6) ? 1 : 0; rkm[ri * 64 + lane] = (unsigned char)rank; wtm[ri * 64 + lane] = wsel / tot * 2.5f; }
        __syncthreads();
    }
    const int nrows = gi * 16;
    if (wave == 0) { unsigned n = 0;
        for (int r = 0; r < nrows; ++r) n += selm[r * 64 + lane];
        unsigned base = 0; if (n && !(PROBE_NOATOM && cnt_shift)) base = __hip_atomic_fetch_add(cnt + 64 * lane, n, __ATOMIC_RELAXED, __HIP_MEMORY_SCOPE_AGENT);
        basem[lane] = base; }
    __syncthreads();
    for (int ri = wave; ri < nrows; ri += 8) { unsigned pos = basem[lane];
        for (int r = 0; r < ri; ++r) pos += selm[r * 64 + lane];
        if (selm[ri * 64 + lane]) { const size_t m = (size_t)(wg + (ri >> 4) * G) * 16 + (ri & 15); const int rk = rkm[ri * 64 + lane];
            LIST[lane * T + pos] = (int)m; WL[lane * T + pos] = wtm[ri * 64 + lane]; SLOT[m * 8 + rk] = ((unsigned)lane << 16) | pos; } }
    __syncthreads();
}
__device__ __forceinline__ void phase_combine_ln2(const Params& p, int l, void* dst, bool dbf, int gw, int NGW, int lane) {
    const bf16* X1 = (const bf16*)(p.ws + WS_X1); const bf16* YE = (const bf16*)(p.ws + WS_YEXP); const unsigned* SLOT = (const unsigned*)(p.ws + WS_SLOT);
    const unsigned* cnt = (const unsigned*)(p.ws + WS_CTL) + CW_CNT + l * 4096;
    const float* g2 = p.in[I_LN2G] + (size_t)l * D; const float* b2 = p.in[I_LN2B] + (size_t)l * D;
    const int tiles = ((int)cnt[64 * lane] + 255) >> 8; const float incl = wave_scan_incl((float)tiles);
    const int toff = (int)incl - tiles;
    const int tsh = __builtin_amdgcn_readlane((int)incl, 63);
    for (int m = gw; m < T; m += NGW) {
        v4f v[8];
#pragma unroll
        for (int j = 0; j < 8; ++j) v[j] = ld4(X1, (size_t)m * D + 4 * lane + 256 * j, true) * ALPHA;
#pragma unroll
        for (int k = 0; k < 7; ++k) { size_t row;
            if (k == 0) row = (size_t)tsh * 256 + m;
            else { const unsigned s = __builtin_amdgcn_readfirstlane(SLOT[(size_t)m * 8 + (k - 1)]); const int e = (int)(s >> 16); row = (size_t)__builtin_amdgcn_readlane(toff, e) * 256 + (s & 0xffffu); }
            const v2u* yr = (const v2u*)(YE + row * D) + lane;
#pragma unroll
            for (int j = 0; j < 8; ++j) { const v2u y = yr[64 * j]; v[j].x += bflo(y.x); v[j].y += bfhi(y.x); v[j].z += bflo(y.y); v[j].w += bfhi(y.y); } }
        float s = 0.f;
#pragma unroll
        for (int j = 0; j < 8; ++j) s += (v[j].x + v[j].y) + (v[j].z + v[j].w);
        const float mean = wave_sum(s) * (1.f / D); float s2 = 0.f;
#pragma unroll
        for (int j = 0; j < 8; ++j) { v[j] = v[j] - mean; s2 += (v[j].x * v[j].x + v[j].y * v[j].y) + (v[j].z * v[j].z + v[j].w * v[j].w); }
        const float rstd = rsqrtf(wave_sum(s2) * (1.f / D) + LN_EPS);
#pragma unroll
        for (int j = 0; j < 8; ++j) { const v4f gg = ((const v4f*)g2)[lane + 64 * j], bb = ((const v4f*)b2)[lane + 64 * j]; const v4f o = v[j] * rstd * gg + bb;
            if (dbf) ((v2u*)((bf16*)dst + (size_t)m * D))[lane + 64 * j] = (v2u){pk2(o.x, o.y), pk2(o.z, o.w)};
            else ((v4f*)((float*)dst + (size_t)m * D))[lane + 64 * j] = o; }
    }
}

constexpr int NPH = 11;
template <class S> struct DupOrder {
    S s; int n;
    __device__ __forceinline__ bool next(int i, Unit& u) const { return s.next(i >= n ? i - n : i, u); }
    __device__ __forceinline__ int row_token(int i, int r) const { return s.row_token(i >= n ? i - n : i, r); }
    __device__ __forceinline__ void a_ready(const Unit& u) const { s.a_ready(u); }
    __device__ __forceinline__ void done(const Unit& u) const { s.done(u); }
};
template <class S> __device__ __forceinline__ int count_units(const S& s) { Unit u; int n = 0; while (n < 64 && s.next(n, u)) ++n; return n; }
#define ORDER_T(k, T) typename std::conditional<PROBE_DUP == (k), DupOrder<T>, T>::type
template <class S> __device__ __forceinline__ DupOrder<S> make_order(const S& s, std::true_type) { DupOrder<S> d{s, count_units(s)}; d.n = count_units(s); return d; }
template <class S> __device__ __forceinline__ S make_order(const S& s, std::false_type) { return s; }
#define MAKE_ORDER(k, s) make_order(s, std::integral_constant<bool, PROBE_DUP == (k)>())
template <int l>
__device__ __forceinline__ void run_layer(const Params& p, LAS unsigned char* lds, const XcdBarrier& bar, int tid, int lane, int wave, int G, int wg, int gw, int NGW) {
    unsigned char* ws = p.ws;
    {
        const void* xin = (l == 0) ? (const void*)p.in[I_X] : (const void*)(ws + WS_XCUR);
        void* xout = (l == NL - 1) ? (void*)p.out : (void*)(ws + WS_XCUR);
#ifndef PROBE_DUP
#define PROBE_DUP (-1)
#endif
#define IS_GEMM_PH(k) ((k) == 1 || (k) == 5 || (k) == 6 || (k) == 8 || (k) == 9)
#define REP(k) _Pragma("nounroll") for (int _r = 0; _r < ((PROBE_DUP == (k) && !IS_GEMM_PH(k)) ? 2 + (p.ph_lo >> 20) : 1); ++_r)
#ifndef PH_MASK
#define PH_MASK 0x7ff
#endif
#define RUN(k) (((PH_MASK >> (k)) & 1) && p.ph_lo <= l * NPH + (k) && l * NPH + (k) < p.ph_hi)
#define SEAM(k) do { if (l * NPH + (k) + 1 < p.ph_hi) xcd_barrier(bar); } while (0)
        if (RUN(0)) { REP(0) { phase_convert<0>(p, l, lds, gw, NGW, wave, lane);
#if defined(PROBE_CONV0)
            phase_convert<1>(p, l, lds, gw, NGW, wave, lane);
#endif
 phase_xprep(p, l, xin, l > 0, lds, gw, NGW, tid, lane); } SEAM(0); }
        if (RUN(1)) { REP(1) { pg8::Gemm g{(const bf16*)(ws + WS_XB), (const bf16*)(ws + WS_WIN), T, ZC, D / 2, D / 2, D / 2}; pg8::StaticOrder S; S.init(T, ZC, G, wg);
            pg8::EpiBf16<0> E{(bf16*)(ws + WS_Z), ZC, nullptr, 0, 0, 1.f / 64.f};
            auto S2 = MAKE_ORDER(1, S); pg8::gemm_phase<pg8::EpiBf16<0>, ORDER_T(1, pg8::StaticOrder), true, true, true>(lds, g, S2, E); } SEAM(1); }
        if (RUN(2)) { REP(2) { for (int it = wg; it < 1536; it += G) { if (it < 512) gdn_pre_item(p, l, lds, it, tid, wave, lane); else if (it < 1024) ml_pre_item(p, l, lds, it - 512, tid, wave, lane); else vt_item(p, lds, it - 1024, tid); } } SEAM(2); }
        if (RUN(3)) { REP(3) { phase_mixers(p, l, lds, wg, G, tid, wave, lane, bar); } SEAM(3); }
        if (RUN(4)) { REP(4) { phase_post(p, l, gw, NGW, lane); } SEAM(4); }
        if (RUN(5)) { REP(5) { constexpr int KM = MERGE_FP8 ? BRW / 2 : BRW; pg8::Gemm g{(const bf16*)(ws + WS_BR), (const bf16*)(ws + WS_WBR), T, D, KM, KM, KM}; pg8::StaticOrder S; S.init(T, D, G, wg);
            EpiMergeH E{(const bf16*)(ws + WS_Z), (bf16*)(ws + WS_MSUM)};
            auto S2 = MAKE_ORDER(5, S); pg8::gemm_phase<EpiMergeH, ORDER_T(5, pg8::StaticOrder), true, true, MERGE_FP8 != 0>(lds, g, S2, E); } SEAM(5); }
        if (RUN(6)) { REP(6) { pg8::Gemm g{(const bf16*)(ws + WS_MSUM), (const bf16*)(ws + WS_WOUT), T, D, D / 2, D / 2, D / 2}; pg8::StaticOrder S; S.init(T, D, G, wg);
            EpiResid E{xin, (bf16*)(ws + WS_Y), 1.f / 64.f, l > 0};
            auto S2 = MAKE_ORDER(6, S); pg8::gemm_phase<EpiResid, ORDER_T(6, pg8::StaticOrder), true, true, true>(lds, g, S2, E); } SEAM(6); }
        if (RUN(7)) { REP(7) { phase_ln1_router(p, l, lds, wg, G, wave, lane, (PROBE_DUP == 7 && _r == 0) ? 16384 : 0); } SEAM(7); }
        if (RUN(8)) { REP(8) { const unsigned* cnt = (const unsigned*)(ws + WS_CTL) + CW_CNT + l * 4096; MoeTab M(lds); moe_tables(M, cnt, tid, lane, wave);
            UpOrder S{M, 0}; S.n = up_order_build(M, (const int*)(ws + WS_LIST), (const float*)(ws + WS_WL), wg, G, tid);
            constexpr int KU = MOE_UP_FP8 ? D / 2 : D;
            pg8::Gemm g{(const bf16*)(ws + WS_X1B), (const bf16*)(ws + WS_WUP), T, NEX * 1024, KU, KU, KU};
            EpiGluSparse E{(LAS const float*)M.wt, (bf16*)(ws + WS_HB)};
            auto S2 = MAKE_ORDER(8, S); pg8::gemm_phase_gather<EpiGluSparse, ORDER_T(8, UpOrder), MOE_UP_FP8 != 0>(lds, g, S2, E); } SEAM(8); }
        if (RUN(9)) { REP(9) { const unsigned* cnt = (const unsigned*)(ws + WS_CTL) + CW_CNT + l * 4096; MoeTab M(lds); moe_tables(M, cnt, tid, lane, wave);
            DownOrder S{M, G, wg, 8 * M.t[65]};
            constexpr int KD = MOE_DN_FP8 ? ED / 2 : ED;
            pg8::Gemm g{(const bf16*)(ws + WS_HB), (const bf16*)(ws + WS_WDN), HROWS, NEX * D, KD, KD, KD};
            EpiYexp E{(bf16*)(ws + WS_YEXP)};
            auto S2 = MAKE_ORDER(9, S); pg8::gemm_phase<EpiYexp, ORDER_T(9, DownOrder), true, true, MOE_DN_FP8 != 0>(lds, g, S2, E); } SEAM(9); }
        if (RUN(10)) { REP(10) { phase_combine_ln2(p, l, xout, l != NL - 1, gw, NGW, lane); } SEAM(10); }
#undef RUN
#undef SEAM
    }
}
__global__ void __launch_bounds__(512, 2) fwd_kernel(Params p) {
    extern __shared__ __attribute__((aligned(16))) unsigned char lds_raw[];
    LAS unsigned char* lds = (LAS unsigned char*)lds_raw;
    const int tid = threadIdx.x, lane = tid & 63, wave = __builtin_amdgcn_readfirstlane(tid >> 6);
    const int G = gridDim.x, wg = blockIdx.x, gw = wg * 8 + wave, NGW = G * 8;
    volatile LAS unsigned* MISC = (volatile LAS unsigned*)(lds + MISC_OFF);
    if (tid < 32) MISC[tid] = 0u;
    __syncthreads();
    unsigned* ctl = (unsigned*)(p.ws + WS_CTL);
    const bool multi = (p.ph_hi - p.ph_lo) > 1;
    XcdBarrier bar; bar.bar = ctl + CW_BAR; bar.x = 0; bar.st = nullptr;
    if (multi) bar = xcd_barrier_post(ctl + CW_BAR, MISC + 8);
    run_layer<0>(p, lds, bar, tid, lane, wave, G, wg, gw, NGW);
    run_layer<1>(p, lds, bar, tid, lane, wave, G, wg, gw, NGW);
}

#ifndef MK_MULTI_LAUNCH
#define MK_MULTI_LAUNCH 0
#endif
extern "C" void kernel_launch(void* const* d_in, const int* in_sizes, int n_in, void* d_out, int out_size, void* d_ws, size_t ws_size, hipStream_t stream) {
    static int grid = 0;
    if (grid == 0) {
        if (n_in != 27 || out_size != T * D || ws_size < WS_END) { fprintf(stderr, "kernel_launch: unexpected shapes (n_in %d out %d ws %zu need %zu)\n", n_in, out_size, ws_size, (size_t)WS_END); grid = -1; return; }
        int dev = 0, cus = 0, per_cu = 0;
        if (hipGetDevice(&dev) != hipSuccess || hipDeviceGetAttribute(&cus, hipDeviceAttributeMultiprocessorCount, dev) != hipSuccess) { grid = -1; return; }
        if (hipFuncSetAttribute((const void*)fwd_kernel, hipFuncAttributeMaxDynamicSharedMemorySize, LDS_BYTES) != hipSuccess) { fprintf(stderr, "kernel_launch: hipFuncSetAttribute failed\n"); grid = -1; return; }
        if (hipOccupancyMaxActiveBlocksPerMultiprocessor(&per_cu, (const void*)fwd_kernel, 512, LDS_BYTES) != hipSuccess || per_cu < 1) { fprintf(stderr, "kernel_launch: occupancy query says %d\n", per_cu); }
        (void)hipGetLastError();
        grid = cus;
    }
    if (grid < 0) return;
    (void)hipMemsetAsync((char*)d_ws + WS_CTL, 0, CTL_ZERO_BYTES, stream);
    Params p{};
    for (int i = 0; i < 27; ++i) p.in[i] = (const float*)d_in[i];
    p.out = (float*)d_out; p.ws = (unsigned char*)d_ws;
#if MK_MULTI_LAUNCH
    for (int ph = 0; ph < NL * NPH; ++ph) { p.ph_lo = ph; p.ph_hi = ph + 1; hipLaunchKernelGGL(fwd_kernel, dim3(grid), dim3(512), LDS_BYTES, stream, p); }
#else
    p.ph_lo = 0; p.ph_hi = NL * NPH; hipLaunchKernelGGL(fwd_kernel, dim3(grid), dim3(512), LDS_BYTES, stream, p);
#endif
}
```

```cpp
#include <hip/hip_runtime.h>
#include <cstdio>
#include <cstdint>
#include <type_traits>
namespace pg8 {
#define PG8_LAS __attribute__((address_space(3)))
typedef unsigned short bf16_t;
typedef short bf16x8 __attribute__((ext_vector_type(8)));
typedef float f32x4 __attribute__((ext_vector_type(4)));
typedef unsigned u32x4 __attribute__((ext_vector_type(4)));
constexpr int BM = 256, BK = 64, HALF = 128, HTB = HALF * BK * 2  , STAGE_BYTES = 8 * HTB, NXCD = 8, WGM = 8;

__host__ __device__ __forceinline__ int lds_byte(int r, int c) { const int st = (r >> 4) * 2 + (c >> 5), rr = r & 15, cc = c & 31, ob = rr * 64 + cc * 2; return st * 1024 + (ob ^ (((ob >> 9) & 1) << 5)); }
__host__ __device__ __forceinline__ void stage_rc(int b, int& R, int& C) { const int st = b / 1024, sb = b % 1024, swz = sb ^ (((sb >> 9) & 1) << 5); R = (st >> 1) * 16 + swz / 64; C = (st & 1) * 32 + (swz % 64) / 2; }
__host__ __device__ __forceinline__ int perm32(int rho) { const int n = rho >> 4, i = rho & 15; return 8 * (i >> 2) + 4 * n + (i & 3); }

struct Unit { int pm, pn, aux; };
struct Gemm { const bf16_t* A; const bf16_t* Bt; int M, N, K, lda, ldb; };

struct StaticOrder {
    int nM, nN, nwg, G, c;
    __host__ __device__ void init(int M, int N, int G_, int c_) { nM = M / BM; nN = N / BM; nwg = nM * nN; G = G_; c = c_; }
    __host__ __device__ bool next(int i, Unit& u) const {
        const long L = (long)i * G + c; if (L >= nwg) return false;
        int wgid = (int)L; { const int q = nwg / NXCD, r = nwg % NXCD, xcd = wgid % NXCD, off = wgid / NXCD; wgid = (xcd < r ? xcd * (q + 1) : r * (q + 1) + (xcd - r) * q) + off; }
        const int nig = WGM * nN, gid = wgid / nig, fm = gid * WGM, gsz = (nM - fm) < WGM ? (nM - fm) : WGM;
        u.pm = fm + ((wgid % nig) % gsz); u.pn = (wgid % nig) / gsz; return true;
    }
    __device__ __forceinline__ void a_ready(const Unit&) const {}
    __device__ __forceinline__ void done(const Unit&) const {}
};

__device__ __forceinline__ unsigned cvt_pk_bf16(float lo, float hi) { unsigned r; asm volatile("v_cvt_pk_bf16_f32 %0, %1, %2" : "=v"(r) : "v"(lo), "v"(hi)); return r; }
typedef float f32x2 __attribute__((ext_vector_type(2)));
__device__ __forceinline__ f32x2 gelu_pk(f32x2 v) {
    const f32x2 av = __builtin_elementwise_abs(v), d = av * 0.2316418882f + 1.0f;
    f32x2 t; t.x = __builtin_amdgcn_rcpf(d.x); t.y = __builtin_amdgcn_rcpf(d.y);
    f32x2 q = t * 0.5307027145f + (-0.7265760135f); q = q * t + 0.7107068705f; q = q * t + (-0.142248368f); q = q * t + 0.127414796f; q = q * t;
    const f32x2 s = (v * v) * (-0.72134752044f);
    f32x2 e; e.x = __builtin_amdgcn_exp2f(s.x); e.y = __builtin_amdgcn_exp2f(s.y);
    const f32x2 m = v * (q * e), r = v - m;
    f32x2 o; o.x = v.x < 0.f ? m.x : r.x; o.y = v.y < 0.f ? m.y : r.y; return o;
}

template <int ACT  > struct EpiBf16 {
    static constexpr bool PERM = true, AFTER_DRAIN = false; static constexpr int MID = 0; static_assert(ACT == 0 || ACT == 1, "EpiBf16: ACT is 0 (none) or 1 (gelu_pk)");
    bf16_t* O; int ldc; const float* bias; int split_cols; size_t split_stride; float scale0;
    __device__ __forceinline__ void operator()(const f32x4 (&acc)[2][2][4][2], const Unit& u, int wr, int wc, int fr, int fq) const {
        const int row0 = u.pm * BM + wr * 64 + fr; int colt = u.pn * BM; bf16_t* base = O;
        float sc = scale0; if (split_cols) { const int t = colt / split_cols; base += (size_t)t * split_stride; colt -= t * split_cols; if (t != 0) sc = 1.f; }
        const int col0 = colt + wc * 32 + 8 * fq, bcol0 = u.pn * BM + wc * 32 + 8 * fq;
        f32x4 bv[2][2];
#pragma unroll
        for (int bj = 0; bj < 2; ++bj)
#pragma unroll
            for (int n = 0; n < 2; ++n) bv[bj][n] = bias ? *(const f32x4*)(bias + bcol0 + bj * HALF + 4 * n) : (f32x4){0.f, 0.f, 0.f, 0.f};
#pragma unroll
        for (int ai = 0; ai < 2; ++ai)
#pragma unroll
            for (int m = 0; m < 4; ++m) { bf16_t* rowp = base + (size_t)(row0 + ai * HALF + m * 16) * ldc + col0;
#pragma unroll
                for (int bj = 0; bj < 2; ++bj) { f32x4 v0 = acc[ai][bj][m][0] + bv[bj][0], v1 = acc[ai][bj][m][1] + bv[bj][1];
                    if (ACT == 1) { f32x2 a = gelu_pk((f32x2){v0[0], v0[1]}), b = gelu_pk((f32x2){v0[2], v0[3]}), c = gelu_pk((f32x2){v1[0], v1[1]}), d = gelu_pk((f32x2){v1[2], v1[3]});
                        v0 = (f32x4){a.x, a.y, b.x, b.y}; v1 = (f32x4){c.x, c.y, d.x, d.y}; }
                    v0 = v0 * sc; v1 = v1 * sc; u32x4 w; w.x = cvt_pk_bf16(v0[0], v0[1]); w.y = cvt_pk_bf16(v0[2], v0[3]); w.z = cvt_pk_bf16(v1[0], v1[1]); w.w = cvt_pk_bf16(v1[2], v1[3]);
                    *(u32x4*)(rowp + bj * HALF) = w; } }
    }
};

typedef int i32x8 __attribute__((ext_vector_type(8)));
__device__ __forceinline__ i32x8 cat8(const bf16x8 a, const bf16x8 b) { typedef int i32x4 __attribute__((ext_vector_type(4))); const i32x4 x = __builtin_bit_cast(i32x4, a), y = __builtin_bit_cast(i32x4, b); return (i32x8){x[0], x[1], x[2], x[3], y[0], y[1], y[2], y[3]}; }
__device__ __forceinline__ bf16x8 lo8(const i32x8 v) { typedef int i32x4 __attribute__((ext_vector_type(4))); return __builtin_bit_cast(bf16x8, __builtin_shufflevector(v, v, 0, 1, 2, 3)); }
__device__ __forceinline__ bf16x8 hi8(const i32x8 v) { typedef int i32x4 __attribute__((ext_vector_type(4))); return __builtin_bit_cast(bf16x8, __builtin_shufflevector(v, v, 4, 5, 6, 7)); }
template <class Epi, class Sched, bool ALIGN_EPI = false, bool SP2 = false, bool FP8 = false>
__device__ __forceinline__ void gemm_phase(PG8_LAS unsigned char* lds, const Gemm g, const Sched& S, const Epi& E) {
    const int tid = threadIdx.x, wid = __builtin_amdgcn_readfirstlane(tid >> 6), lane = tid & 63, wr = wid >> 2, wc = wid & 3, fr = lane & 15, fq = lane >> 4;
    const int K = g.K, nt = K / BK;
    unsigned voffA[2], voffB[2];
#pragma unroll
    for (int i = 0; i < 2; ++i) { int R, C; stage_rc(tid * 16 + i * 8192, R, C); const int Rb = Epi::PERM ? ((R & ~31) + perm32(R & 31)) : R;
        voffA[i] = (unsigned)(R * g.lda + C) * 2u; voffB[i] = (unsigned)(Rb * g.ldb + C) * 2u; }
    const size_t kstep = (size_t)(BK * 2);
    const size_t hstepA = (size_t)HALF * g.lda * 2, hstepB = (size_t)HALF * g.ldb * 2;
    const size_t tstepA = 2 * hstepA, tstepB = 2 * hstepB;
    const unsigned ldsw = (unsigned)wid * 1024u;
    const int aoff = lds_byte(wr * 64 + fr, fq * 8), boff = lds_byte(wc * 32 + fr, fq * 8);
#define PG8_SA(b, h) (((b) * 2 + (h)) * HTB)
#define PG8_SB(b, h) ((4 + (b) * 2 + (h)) * HTB)
#define PG8_STAGE(bufoff, gbase, voff) do { _Pragma("unroll") for (int _i = 0; _i < 2; ++_i) \
        __builtin_amdgcn_global_load_lds((const unsigned*)((const char*)(gbase) + (voff)[_i]), (PG8_LAS unsigned*)(lds + (bufoff) + ldsw + _i * 8192), 16, 0, 0); } while (0)
#define PG8_LDA(dst, b, h) do { _Pragma("unroll") for (int m = 0; m < 4; ++m) { if constexpr (FP8) dst##8[m] = cat8(*(const PG8_LAS bf16x8*)(lds + PG8_SA(b, h) + aoff + m * 2048), *(const PG8_LAS bf16x8*)(lds + PG8_SA(b, h) + aoff + m * 2048 + 1024)); \
        else { _Pragma("unroll") for (int k = 0; k < 2; ++k) dst[m][k] = *(const PG8_LAS bf16x8*)(lds + PG8_SA(b, h) + aoff + m * 2048 + k * 1024); } } } while (0)
#define PG8_LDB(dst, b, h) do { _Pragma("unroll") for (int n = 0; n < 2; ++n) { if constexpr (FP8) dst##8[n] = cat8(*(const PG8_LAS bf16x8*)(lds + PG8_SB(b, h) + boff + n * 2048), *(const PG8_LAS bf16x8*)(lds + PG8_SB(b, h) + boff + n * 2048 + 1024)); \
        else { _Pragma("unroll") for (int k = 0; k < 2; ++k) dst[n][k] = *(const PG8_LAS bf16x8*)(lds + PG8_SB(b, h) + boff + n * 2048 + k * 1024); } } } while (0)
#define PG8_MMA(ai, bj, At, Bt) do { __builtin_amdgcn_s_setprio(1); _Pragma("unroll") for (int m = 0; m < 4; ++m) _Pragma("unroll") for (int n = 0; n < 2; ++n) { \
        if constexpr (FP8) asm volatile("v_mfma_scale_f32_16x16x128_f8f6f4 %0, %1, %2, %0, %3, %3 op_sel_hi:[0,0,0]" : "+v"(acc[ai][bj][m][n]) : "v"(Bt##8[n]), "v"(At##8[m]), "v"(fp8_unit_scale)); \
        else { _Pragma("unroll") for (int k = 0; k < 2; ++k) acc[ai][bj][m][n] = __builtin_amdgcn_mfma_f32_16x16x32_bf16(Bt[n][k], At[m][k], acc[ai][bj][m][n], 0, 0, 0); } } __builtin_amdgcn_s_setprio(0); } while (0)
#define PG8_WAIT_V(n) asm volatile("s_waitcnt vmcnt(" #n ")" ::: "memory")
#define PG8_WAIT_L(n) asm volatile("s_waitcnt lgkmcnt(" #n ")" ::: "memory")
#define PG8_BAR __builtin_amdgcn_s_barrier()
#define PG8_SCHED __builtin_amdgcn_sched_barrier(0)
    Unit cur, nxt; int ui = 0;
    if (!S.next(0, cur)) return;
    f32x4 acc[2][2][4][2];
#pragma unroll
    for (int a = 0; a < 2; ++a)
#pragma unroll
        for (int b = 0; b < 2; ++b)
#pragma unroll
            for (int m = 0; m < 4; ++m)
#pragma unroll
                for (int n = 0; n < 2; ++n) acc[a][b][m][n] = (f32x4){0.f, 0.f, 0.f, 0.f};
    int fp8_unit_scale = 0x7F7F7F7F; asm volatile("" : "+v"(fp8_unit_scale));
    bf16x8 At[4][2], B0[2][2], B1[2][2];
    i32x8 At8[4], B08[2], B18[2];
    const char* cA = (const char*)g.A + (size_t)cur.pm * tstepA; const char* cB = (const char*)g.Bt + (size_t)cur.pn * tstepB;
    S.a_ready(cur);
    if constexpr (SP2) {
        PG8_STAGE(PG8_SB(0, 0), cB, voffB); PG8_STAGE(PG8_SB(0, 1), cB + hstepB, voffB); PG8_STAGE(PG8_SA(0, 0), cA, voffA); PG8_STAGE(PG8_SA(0, 1), cA + hstepA, voffA);
        if (wr == 1) PG8_BAR;
        PG8_WAIT_V(2); PG8_BAR;
        PG8_STAGE(PG8_SB(1, 0), cB + kstep, voffB); PG8_STAGE(PG8_SA(1, 0), cA + kstep, voffA); PG8_STAGE(PG8_SB(1, 1), cB + hstepB + kstep, voffB);
        PG8_WAIT_V(6); PG8_BAR;
    } else {
        PG8_STAGE(PG8_SB(0, 0), cB, voffB); PG8_STAGE(PG8_SA(0, 0), cA, voffA); PG8_STAGE(PG8_SB(0, 1), cB + hstepB, voffB); PG8_STAGE(PG8_SA(0, 1), cA + hstepA, voffA);
        if (wr == 1) PG8_BAR;
        PG8_WAIT_V(4); PG8_BAR;
        PG8_STAGE(PG8_SB(1, 0), cB + kstep, voffB); PG8_STAGE(PG8_SA(1, 0), cA + kstep, voffA); PG8_STAGE(PG8_SB(1, 1), cB + hstepB + kstep, voffB);
        PG8_WAIT_V(6); PG8_BAR;
    }
    for (;;) {
        const bool has_next = S.next(ui + 1, nxt);
        const char* nA = has_next ? (const char*)g.A + (size_t)nxt.pm * tstepA : cA; const char* nB = has_next ? (const char*)g.Bt + (size_t)nxt.pn * tstepB : cB;
        for (int t = 0; t < nt; t += 2) {
            const bool last = (t == nt - 2);
            const char* a1 = cA + (size_t)(t + 1) * kstep;
            const char* a2 = last ? nA : cA + (size_t)(t + 2) * kstep; const char* b2 = last ? nB : cB + (size_t)(t + 2) * kstep;
            const char* a3 = a2 + kstep; const char* b3 = b2 + kstep;
            if (last && has_next) S.a_ready(nxt);
            if constexpr (SP2) {
            if constexpr (Epi::MID > 0) { if (t != 0 && (t % Epi::MID) == 0) { PG8_SCHED; if constexpr (FP8) asm volatile("s_nop 7\n\ts_nop 7" ::: "memory"); E.mid(acc, cur, t / Epi::MID, wr, wc, fr, fq); if constexpr (FP8) asm volatile("s_nop 7" ::: "memory"); PG8_SCHED; } }
            PG8_LDB(B0, 0, 0); PG8_LDB(B1, 0, 1); PG8_SCHED; PG8_LDA(At, 0, 0); PG8_STAGE(PG8_SA(1, 1), a1 + hstepA, voffA);
            PG8_WAIT_V(8); PG8_WAIT_L(0); PG8_BAR; PG8_MMA(0, 0, At, B0); PG8_MMA(0, 1, At, B1); PG8_BAR; PG8_SCHED;
            PG8_LDA(At, 0, 1); PG8_STAGE(PG8_SB(0, 0), b2, voffB); PG8_STAGE(PG8_SB(0, 1), b2 + hstepB, voffB); PG8_STAGE(PG8_SA(0, 0), a2, voffA);
            PG8_WAIT_V(8); PG8_WAIT_L(0); PG8_BAR; PG8_MMA(1, 0, At, B0); PG8_MMA(1, 1, At, B1); PG8_BAR; PG8_SCHED;
            PG8_LDB(B0, 1, 0); PG8_LDB(B1, 1, 1); PG8_SCHED; PG8_LDA(At, 1, 0); PG8_STAGE(PG8_SA(0, 1), a2 + hstepA, voffA);
            PG8_WAIT_V(8); PG8_WAIT_L(0); PG8_BAR; PG8_MMA(0, 0, At, B0); PG8_MMA(0, 1, At, B1); PG8_BAR; PG8_SCHED;
            PG8_LDA(At, 1, 1); PG8_STAGE(PG8_SB(1, 0), b3, voffB); PG8_STAGE(PG8_SB(1, 1), b3 + hstepB, voffB); PG8_STAGE(PG8_SA(1, 0), a3, voffA);
            PG8_WAIT_V(8); PG8_WAIT_L(0); PG8_BAR; PG8_MMA(1, 0, At, B0); PG8_MMA(1, 1, At, B1); PG8_BAR; PG8_SCHED;
            } else {
            PG8_LDB(B0, 0, 0); PG8_SCHED; PG8_LDA(At, 0, 0); PG8_STAGE(PG8_SA(1, 1), a1 + hstepA, voffA);
            PG8_WAIT_L(8); PG8_BAR; PG8_WAIT_L(0); PG8_MMA(0, 0, At, B0); PG8_BAR; PG8_SCHED;
            PG8_LDB(B1, 0, 1); PG8_STAGE(PG8_SB(0, 0), b2, voffB);
            PG8_BAR; PG8_WAIT_L(0); PG8_MMA(0, 1, At, B1); PG8_BAR;
            PG8_LDA(At, 0, 1); PG8_STAGE(PG8_SA(0, 0), a2, voffA);
            PG8_BAR; PG8_WAIT_L(0); PG8_MMA(1, 0, At, B0); PG8_BAR; PG8_SCHED;
            PG8_STAGE(PG8_SB(0, 1), b2 + hstepB, voffB);
            PG8_WAIT_V(6); PG8_BAR; PG8_MMA(1, 1, At, B1); PG8_BAR;
            PG8_LDB(B0, 1, 0); PG8_SCHED; PG8_LDA(At, 1, 0); PG8_STAGE(PG8_SA(0, 1), a2 + hstepA, voffA);
            PG8_WAIT_L(8); PG8_BAR; PG8_WAIT_L(0); PG8_MMA(0, 0, At, B0); PG8_BAR; PG8_SCHED;
            PG8_LDB(B1, 1, 1); PG8_STAGE(PG8_SB(1, 0), b3, voffB);
            PG8_BAR; PG8_WAIT_L(0); PG8_MMA(0, 1, At, B1); PG8_BAR;
            PG8_LDA(At, 1, 1); PG8_STAGE(PG8_SA(1, 0), a3, voffA);
            PG8_BAR; PG8_WAIT_L(0); PG8_MMA(1, 0, At, B0); PG8_BAR; PG8_SCHED;
            PG8_STAGE(PG8_SB(1, 1), b3 + hstepB, voffB);
            PG8_WAIT_V(6); PG8_BAR; PG8_MMA(1, 1, At, B1); PG8_BAR;
            }
        }
        if constexpr (ALIGN_EPI) { if (wr == 0) PG8_BAR; }
        if constexpr (FP8) asm volatile("s_nop 7\n\ts_nop 7" ::: "memory");
        if constexpr (!Epi::AFTER_DRAIN) { E(acc, cur, wr, wc, fr, fq); S.done(cur); }
        if (!has_next) break;
#pragma unroll
        for (int a = 0; a < 2; ++a)
#pragma unroll
            for (int b = 0; b < 2; ++b)
#pragma unroll
                for (int m = 0; m < 4; ++m)
#pragma unroll
                    for (int n = 0; n < 2; ++n) acc[a][b][m][n] = (f32x4){0.f, 0.f, 0.f, 0.f};
        cur = nxt; cA = nA; cB = nB; ++ui;
        if constexpr (ALIGN_EPI) { if (wr == 1) PG8_BAR; }
    }
    PG8_WAIT_V(0);
    if constexpr (!ALIGN_EPI) { if (wr == 0) PG8_BAR; }
    PG8_BAR;
    if constexpr (Epi::AFTER_DRAIN) { E.fused(acc, cur, wr, wc, fr, fq, lds, wid, lane); S.done(cur); }
#undef PG8_SA
#undef PG8_SB
#undef PG8_STAGE
#undef PG8_LDA
#undef PG8_LDB
#undef PG8_MMA
#undef PG8_WAIT_V
#undef PG8_WAIT_L
#undef PG8_BAR
#undef PG8_SCHED
}
template <class Epi, class Sched, bool FP8 = false>
__device__ __forceinline__ void gemm_phase_gather(PG8_LAS unsigned char* lds, const Gemm g, const Sched& S, const Epi& E) {
    const int tid = threadIdx.x, wid = __builtin_amdgcn_readfirstlane(tid >> 6), lane = tid & 63, wr = wid >> 2, wc = wid & 3, fr = lane & 15, fq = lane >> 4;
    const int K = g.K, nt = K / BK;
    unsigned voffB[2]; int RA[2], CA[2];
#pragma unroll
    for (int i = 0; i < 2; ++i) { int R, C; stage_rc(tid * 16 + i * 8192, R, C); const int Rb = Epi::PERM ? ((R & ~31) + perm32(R & 31)) : R;
        RA[i] = R; CA[i] = C; voffB[i] = (unsigned)(Rb * g.ldb + C) * 2u; }
    const size_t kstep = (size_t)(BK * 2);
    const size_t hstepB = (size_t)HALF * g.ldb * 2, tstepB = 2 * hstepB;
    const unsigned ldsw = (unsigned)wid * 1024u;
    const int aoff = lds_byte(wr * 64 + fr, fq * 8), boff = lds_byte(wc * 32 + fr, fq * 8);
#define PG8_SA(b, h) (((b) * 2 + (h)) * HTB)
#define PG8_SB(b, h) ((4 + (b) * 2 + (h)) * HTB)
#define PG8_STAGE(bufoff, gbase, voff) do { _Pragma("unroll") for (int _i = 0; _i < 2; ++_i) \
        __builtin_amdgcn_global_load_lds((const unsigned*)((const char*)(gbase) + (voff)[_i]), (PG8_LAS unsigned*)(lds + (bufoff) + ldsw + _i * 8192), 16, 0, 0); } while (0)
#define PG8_LDA(dst, b, h) do { _Pragma("unroll") for (int m = 0; m < 4; ++m) { if constexpr (FP8) dst##8[m] = cat8(*(const PG8_LAS bf16x8*)(lds + PG8_SA(b, h) + aoff + m * 2048), *(const PG8_LAS bf16x8*)(lds + PG8_SA(b, h) + aoff + m * 2048 + 1024)); \
        else { _Pragma("unroll") for (int k = 0; k < 2; ++k) dst[m][k] = *(const PG8_LAS bf16x8*)(lds + PG8_SA(b, h) + aoff + m * 2048 + k * 1024); } } } while (0)
#define PG8_LDB(dst, b, h) do { _Pragma("unroll") for (int n = 0; n < 2; ++n) { if constexpr (FP8) dst##8[n] = cat8(*(const PG8_LAS bf16x8*)(lds + PG8_SB(b, h) + boff + n * 2048), *(const PG8_LAS bf16x8*)(lds + PG8_SB(b, h) + boff + n * 2048 + 1024)); \
        else { _Pragma("unroll") for (int k = 0; k < 2; ++k) dst[n][k] = *(const PG8_LAS bf16x8*)(lds + PG8_SB(b, h) + boff + n * 2048 + k * 1024); } } } while (0)
#define PG8_MMA(ai, bj, At, Bt) do { __builtin_amdgcn_s_setprio(1); _Pragma("unroll") for (int m = 0; m < 4; ++m) _Pragma("unroll") for (int n = 0; n < 2; ++n) { \
        if constexpr (FP8) asm volatile("v_mfma_scale_f32_16x16x128_f8f6f4 %0, %1, %2, %0, %3, %3 op_sel_hi:[0,0,0]" : "+v"(acc[ai][bj][m][n]) : "v"(Bt##8[n]), "v"(At##8[m]), "v"(fp8_unit_scale)); \
        else { _Pragma("unroll") for (int k = 0; k < 2; ++k) acc[ai][bj][m][n] = __builtin_amdgcn_mfma_f32_16x16x32_bf16(Bt[n][k], At[m][k], acc[ai][bj][m][n], 0, 0, 0); } } __builtin_amdgcn_s_setprio(0); } while (0)
#define PG8_WAIT_V(n) asm volatile("s_waitcnt vmcnt(" #n ")" ::: "memory")
#define PG8_WAIT_L(n) asm volatile("s_waitcnt lgkmcnt(" #n ")" ::: "memory")
#define PG8_BAR __builtin_amdgcn_s_barrier()
#define PG8_SCHED __builtin_amdgcn_sched_barrier(0)
#define PG8_ROWS(dst, ui_) do { _Pragma("unroll") for (int _h = 0; _h < 2; ++_h) _Pragma("unroll") for (int _i = 0; _i < 2; ++_i) \
        dst[_h][_i] = (unsigned)S.row_token((ui_), _h * HALF + RA[_i]) * (unsigned)(g.lda * 2) + (unsigned)(CA[_i] * 2); } while (0)
    Unit cur, nxt; int ui = 0;
    if (!S.next(0, cur)) return;
    f32x4 acc[2][2][4][2];
#pragma unroll
    for (int a = 0; a < 2; ++a)
#pragma unroll
        for (int b = 0; b < 2; ++b)
#pragma unroll
            for (int m = 0; m < 4; ++m)
#pragma unroll
                for (int n = 0; n < 2; ++n) acc[a][b][m][n] = (f32x4){0.f, 0.f, 0.f, 0.f};
    int fp8_unit_scale = 0x7F7F7F7F; asm volatile("" : "+v"(fp8_unit_scale));
    bf16x8 At[4][2], B0[2][2], B1[2][2];
    i32x8 At8[4], B08[2], B18[2];
    unsigned offC[2][2];
    PG8_ROWS(offC, 0);
    const char* gA = (const char*)g.A;
    const char* cB = (const char*)g.Bt + (size_t)cur.pn * tstepB;
    PG8_STAGE(PG8_SB(0, 0), cB, voffB); PG8_STAGE(PG8_SB(0, 1), cB + hstepB, voffB); PG8_STAGE(PG8_SA(0, 0), gA, offC[0]); PG8_STAGE(PG8_SA(0, 1), gA, offC[1]);
    if (wr == 1) PG8_BAR;
    PG8_WAIT_V(2); PG8_BAR;
    PG8_STAGE(PG8_SB(1, 0), cB + kstep, voffB); PG8_STAGE(PG8_SA(1, 0), gA + kstep, offC[0]); PG8_STAGE(PG8_SB(1, 1), cB + hstepB + kstep, voffB);
    PG8_WAIT_V(6); PG8_BAR;
    for (;;) {
        const bool has_next = S.next(ui + 1, nxt);
        const char* nB = has_next ? (const char*)g.Bt + (size_t)nxt.pn * tstepB : cB;
        for (int t = 0; t < nt; t += 2) {
            const bool last = (t == nt - 2);
            const char* a1 = gA + (size_t)(t + 1) * kstep;
            const char* a2 = last ? gA : gA + (size_t)(t + 2) * kstep; const char* b2 = last ? nB : cB + (size_t)(t + 2) * kstep;
            const char* a3 = a2 + kstep; const char* b3 = b2 + kstep;
            PG8_LDB(B0, 0, 0); PG8_LDB(B1, 0, 1); PG8_SCHED; PG8_LDA(At, 0, 0); PG8_STAGE(PG8_SA(1, 1), a1, offC[1]);
            if (last && has_next) { PG8_ROWS(offC, ui + 1); }
            PG8_WAIT_V(8); PG8_WAIT_L(0); PG8_BAR; PG8_MMA(0, 0, At, B0); PG8_MMA(0, 1, At, B1); PG8_BAR; PG8_SCHED;
            PG8_LDA(At, 0, 1); PG8_STAGE(PG8_SB(0, 0), b2, voffB); PG8_STAGE(PG8_SB(0, 1), b2 + hstepB, voffB); PG8_STAGE(PG8_SA(0, 0), a2, offC[0]);
            PG8_WAIT_V(8); PG8_WAIT_L(0); PG8_BAR; PG8_MMA(1, 0, At, B0); PG8_MMA(1, 1, At, B1); PG8_BAR; PG8_SCHED;
            PG8_LDB(B0, 1, 0); PG8_LDB(B1, 1, 1); PG8_SCHED; PG8_LDA(At, 1, 0); PG8_STAGE(PG8_SA(0, 1), a2, offC[1]);
            PG8_WAIT_V(8); PG8_WAIT_L(0); PG8_BAR; PG8_MMA(0, 0, At, B0); PG8_MMA(0, 1, At, B1); PG8_BAR; PG8_SCHED;
            PG8_LDA(At, 1, 1); PG8_STAGE(PG8_SB(1, 0), b3, voffB); PG8_STAGE(PG8_SB(1, 1), b3 + hstepB, voffB); PG8_STAGE(PG8_SA(1, 0), a3, offC[0]);
            PG8_WAIT_V(8); PG8_WAIT_L(0); PG8_BAR; PG8_MMA(1, 0, At, B0); PG8_MMA(1, 1, At, B1); PG8_BAR; PG8_SCHED;
        }
        if (wr == 0) PG8_BAR;
        if constexpr (FP8) asm volatile("s_nop 7\n\ts_nop 7" ::: "memory");
        E(acc, cur, wr, wc, fr, fq); S.done(cur);
        if (!has_next) break;
#pragma unroll
        for (int a = 0; a < 2; ++a)
#pragma unroll
            for (int b = 0; b < 2; ++b)
#pragma unroll
                for (int m = 0; m < 4; ++m)
#pragma unroll
                    for (int n = 0; n < 2; ++n) acc[a][b][m][n] = (f32x4){0.f, 0.f, 0.f, 0.f};
        cur = nxt; cB = nB; ++ui;
        if (wr == 1) PG8_BAR;
    }
    PG8_WAIT_V(0);
    PG8_BAR;
#undef PG8_ROWS
#undef PG8_SA
#undef PG8_SB
#undef PG8_STAGE
#undef PG8_LDA
#undef PG8_LDB
#undef PG8_MMA
#undef PG8_WAIT_V
#undef PG8_WAIT_L
#undef PG8_BAR
#undef PG8_SCHED
}
}

#ifndef MERGE_FP8
#define MERGE_FP8 1
#endif
#ifndef MOE_DN_FP8
#define MOE_DN_FP8 1
#endif
#ifndef MOE_UP_FP8
#define MOE_UP_FP8 1
#endif
#ifndef PROBE_NOATOM
#define PROBE_NOATOM 0
#endif
constexpr int T = 8192, D = 2048, NL = 2, BW = 512, ZC = 14336, INC = 14352;
constexpr int NE = 64, NEX = 65  , ED = 512;
constexpr int BRW = 4 * BW;
constexpr int HK = NEX * ED;
constexpr float ALPHA = 1.41421356237f;
constexpr float LN_EPS = 1e-5f;
constexpr float UPSC = MOE_UP_FP8 ? (1.f / 64.f) : 1.f;
constexpr float BRSC = MERGE_FP8 ? 8.f : 1.f, MGSC = MERGE_FP8 ? (1.f / (8.f * 64.f)) : 1.f;
constexpr float HSC = 8.f, DNSC = MOE_DN_FP8 ? (1.f / (HSC * 64.f)) : 1.f;
constexpr int ZC_SBQ = 0, ZC_SBK = 512, ZC_SBV = 1024, ZC_GMU = 1536, ZC_GMV = 2048, ZC_GDN = 2560, ZC_GDNG = 4096,
              ZC_MLQ = 4608, ZC_MLK = 4864, ZC_MLV = 5120, ZC_MLO = 5632, ZC_GATE = 6144;

#define GAS __attribute__((address_space(1)))
#define LAS __attribute__((address_space(3)))
typedef unsigned short bf16;
typedef unsigned v4u __attribute__((ext_vector_type(4)));
typedef unsigned v2u __attribute__((ext_vector_type(2)));
typedef float v4f __attribute__((ext_vector_type(4)));
typedef float v2f __attribute__((ext_vector_type(2)));
#define LDS_WAIT() asm volatile("s_waitcnt lgkmcnt(0)" ::: "memory")
#define LDS_BAR() do { asm volatile("s_waitcnt lgkmcnt(0)" ::: "memory"); __builtin_amdgcn_s_barrier(); asm volatile("" ::: "memory"); } while (0)

constexpr size_t MiB = 1u << 20;
constexpr size_t WS_CTL = 0, CTL_ZERO_BYTES = 1 * MiB;
constexpr size_t WS_WIN = 2 * MiB, WS_WBR = 58 * MiB, WS_WOUT = 66 * MiB, WS_WUP = 74 * MiB, WS_WDN = 334 * MiB;
constexpr size_t WS_XB = 464 * MiB, WS_SMALL = 496 * MiB, WS_EG = 497 * MiB, WS_BETA = WS_EG + 256 * 1024, WS_COMB = 498 * MiB;
constexpr size_t WS_Z = 500 * MiB, WS_GQ = 724 * MiB, WS_GK = 740 * MiB, WS_GV = 756 * MiB, WS_GO = 772 * MiB, WS_HO = 788 * MiB;
constexpr size_t WS_BR = 804 * MiB, WS_MTMP = 836 * MiB, WS_MSUM = 900 * MiB, WS_Y = 932 * MiB, WS_X1 = 996 * MiB, WS_X1B = 1060 * MiB;
constexpr size_t WS_XCUR = 1092 * MiB, WS_HB = 1156 * MiB, WS_YEXP = 1236 * MiB, WS_LIST = 1524 * MiB, WS_WL = 1526 * MiB, WS_SLOT = 1528 * MiB, WS_MQ = 1530 * MiB, WS_MS = 1534 * MiB, WS_MK = 1538 * MiB, WS_MV = 1542 * MiB, WS_MFL = 1552 * MiB, WS_HDEN = WS_MFL + 65536, WS_VT = 1553 * MiB, WS_END = 1561 * MiB;
constexpr size_t WS_GU = WS_GQ, WS_GNW = WS_GK, WS_GQG = WS_GK + 8 * MiB, WS_GKT = WS_GV, WS_GAT = WS_GV + 8 * MiB, WS_GDL = WS_GV + 12 * MiB;
constexpr int HROWS = 73728;
static_assert(WS_HB + (size_t)HROWS * ED * 2 <= WS_YEXP && WS_YEXP + (size_t)HROWS * D * 2 <= WS_LIST, "ws map (moe)");
static_assert(WS_WIN + (size_t)ZC * D * 2 <= WS_WBR && WS_WUP + (size_t)NEX * 1024 * D * 2 <= WS_WDN && WS_WDN + (size_t)D * HK * 2 <= WS_XB, "ws map (weights)");
static_assert(WS_Z + (size_t)T * ZC * 2 <= WS_GQ, "ws map (acts)");
constexpr int CW_BAR = 4096, CW_CNT = 16384;
constexpr int TAB_OFF = 131072 + 1024;
constexpr int LDS_BYTES = 163840, MISC_OFF = 131072 + 320;

__device__ __forceinline__ float bflo(unsigned w) { return __uint_as_float(w << 16); }
__device__ __forceinline__ float bfhi(unsigned w) { return __uint_as_float(w & 0xffff0000u); }
__device__ __forceinline__ unsigned f2bf(float f) { unsigned u = __float_as_uint(f); return (u + 0x7fffu + ((u >> 16) & 1u)) >> 16; }
__device__ __forceinline__ unsigned pk2(float lo, float hi) { return f2bf(lo) | (f2bf(hi) << 16); }
__device__ __forceinline__ unsigned pk4_f8(float a, float b, float c, float d, float sc) {
    a = __builtin_amdgcn_fmed3f(a * sc, -448.f, 448.f); b = __builtin_amdgcn_fmed3f(b * sc, -448.f, 448.f); c = __builtin_amdgcn_fmed3f(c * sc, -448.f, 448.f); d = __builtin_amdgcn_fmed3f(d * sc, -448.f, 448.f);
    unsigned w = 0; w = __builtin_amdgcn_cvt_pk_fp8_f32(a, b, w, false); w = __builtin_amdgcn_cvt_pk_fp8_f32(c, d, w, true); return w; }
__device__ __forceinline__ v4f ld4(const void* base, size_t idx, bool is_bf16) {
    if (is_bf16) { const v2u r = *(const v2u*)((const unsigned short*)base + idx); return (v4f){bflo(r.x), bfhi(r.x), bflo(r.y), bfhi(r.y)}; }
    return *(const v4f*)((const float*)base + idx); }
template <int CTRL> __device__ __forceinline__ float dpp(float x) { return __builtin_bit_cast(float, __builtin_amdgcn_mov_dpp(__builtin_bit_cast(int, x), CTRL, 0xf, 0xf, true)); }
__device__ __forceinline__ float sum4(float x) { x += dpp<0xB1>(x); x += dpp<0x4E>(x); return x; }
__device__ __forceinline__ float sum8(float x) { x = sum4(x); x += dpp<0x141>(x); return x; }
__device__ __forceinline__ float sum16(float x) { x = sum8(x); x += dpp<0x140>(x); return x; }
__device__ __forceinline__ float wave_sum(float x) { x = sum16(x); x += __shfl_xor(x, 16); x += __shfl_xor(x, 32); return x; }
__device__ __forceinline__ float max8(float x) { x = fmaxf(x, dpp<0xB1>(x)); x = fmaxf(x, dpp<0x4E>(x)); x = fmaxf(x, dpp<0x141>(x)); return x; }
__device__ __forceinline__ float min8(float x) { x = fminf(x, dpp<0xB1>(x)); x = fminf(x, dpp<0x4E>(x)); x = fminf(x, dpp<0x141>(x)); return x; }
__device__ __forceinline__ float wave_scan_incl(float v) {
    v += __builtin_bit_cast(float, __builtin_amdgcn_update_dpp(0, __builtin_bit_cast(int, v), 0x111, 0xf, 0xf, true));
    v += __builtin_bit_cast(float, __builtin_amdgcn_update_dpp(0, __builtin_bit_cast(int, v), 0x112, 0xf, 0xf, true));
    v += __builtin_bit_cast(float, __builtin_amdgcn_update_dpp(0, __builtin_bit_cast(int, v), 0x114, 0xf, 0xf, true));
    v += __builtin_bit_cast(float, __builtin_amdgcn_update_dpp(0, __builtin_bit_cast(int, v), 0x118, 0xf, 0xf, true));
    v += __builtin_bit_cast(float, __builtin_amdgcn_update_dpp(0, __builtin_bit_cast(int, v), 0x142, 0xa, 0xf, false));
    v += __builtin_bit_cast(float, __builtin_amdgcn_update_dpp(0, __builtin_bit_cast(int, v), 0x143, 0xc, 0xf, false));
    return v;
}
__device__ __forceinline__ float sigmoidf_(float x) { return 1.f / (1.f + __expf(-x)); }
__device__ __forceinline__ float siluf_(float x) { return x / (1.f + __expf(-x)); }
__device__ __forceinline__ float softplusf_(float x) { return fmaxf(x, 0.f) + __logf(1.f + __expf(-fabsf(x))); }
__device__ __forceinline__ float gelu_tanh(float x) { const float y = 0.7978845608f * (x + 0.044715f * x * x * x); const float t = 1.f - 2.f / (__expf(2.f * y) + 1.f); return 0.5f * x * (1.f + t); }
__device__ __forceinline__ void unpack8(const v4u r, float (&f)[8]) { f[0] = bflo(r.x); f[1] = bfhi(r.x); f[2] = bflo(r.y); f[3] = bfhi(r.y); f[4] = bflo(r.z); f[5] = bfhi(r.z); f[6] = bflo(r.w); f[7] = bfhi(r.w); }
#define XB_TMO      128
#define XB_XCNT(j)  (256  + 64 * (j))
#define XB_XSUB(j)  (1280 + 64 * (j))
#define XB_XGEN(j)  (2304 + 64 * (j))
#define XB_TOP      3328
#define XB_TOPGEN   3392
#define XCD_BAR_WORDS 3456
#define XB_SPIN_CAP (1u << 18)

__device__ __forceinline__ unsigned xb_ld(unsigned* p)              { return __hip_atomic_load(p, __ATOMIC_RELAXED, __HIP_MEMORY_SCOPE_AGENT); }
__device__ __forceinline__ unsigned xb_add(unsigned* p, unsigned v) { return __hip_atomic_fetch_add(p, v, __ATOMIC_RELAXED, __HIP_MEMORY_SCOPE_AGENT); }
__device__ __forceinline__ unsigned xb_xcc_id() { return (unsigned)__builtin_amdgcn_s_getreg((3 << 11) | 20) & 0xFu; }
#define XB_SPIN(cond, bar) do { unsigned _sp = 0; while (cond) { __builtin_amdgcn_s_sleep(1); \
    if ((++_sp & 255u) == 0u) { if (xb_ld(&(bar)[XB_TMO])) break; if (_sp > XB_SPIN_CAP) { atomicAdd(&(bar)[XB_TMO], 1u); break; } } } } while (0)

struct XcdBarrier {
    unsigned* bar; unsigned x;
    volatile LAS unsigned* st;
};

__device__ __forceinline__ XcdBarrier xcd_barrier_post(unsigned* bar, volatile LAS unsigned* st) {
    XcdBarrier b; b.bar = bar; b.x = xb_xcc_id(); b.st = st;
    if (threadIdx.x == 0) (void)xb_add(&bar[XB_XCNT(b.x)], 1u);
    return b;
}
__device__ __forceinline__ void xcd_barrier_complete(unsigned* bar, unsigned x, unsigned& nloc, unsigned& nx) {
    const unsigned G = gridDim.x * gridDim.y * gridDim.z;
    unsigned sum, cnt, mine, sp = 0u;
    for (;;) {
        sum = 0u; cnt = 0u; mine = 0u;
#pragma unroll
        for (unsigned j = 0; j < 16; ++j) { const unsigned c = xb_ld(&bar[XB_XCNT(j)]); sum += c; cnt += (c > 0u) ? 1u : 0u; mine = (j == x) ? c : mine; }
        if (sum == G) break;
        __builtin_amdgcn_s_sleep(1);
        if ((++sp & 255u) == 0u) { if (xb_ld(&bar[XB_TMO])) break; if (sp > XB_SPIN_CAP) { atomicAdd(&bar[XB_TMO], 1u); break; } }
    }
    nloc = mine > 0u ? mine : 1u; nx = cnt > 0u ? cnt : 1u;
}

__device__ __forceinline__ void xcd_barrier(const XcdBarrier& b) {
    asm volatile("s_waitcnt vmcnt(0)" ::: "memory");
    __syncthreads();
    if (threadIdx.x == 0) {
        unsigned* bar = b.bar;
        __builtin_amdgcn_s_waitcnt(0);
        unsigned nloc = b.st[0], nx = b.st[1];
        if (nloc == 0u) { xcd_barrier_complete(bar, b.x, nloc, nx); b.st[0] = nloc; b.st[1] = nx; }
        const unsigned old = xb_add(&bar[XB_XSUB(b.x)], 1u);
        const unsigned gen = old / nloc;
        if (old + 1u == (gen + 1u) * nloc) {
            __builtin_amdgcn_fence(__ATOMIC_RELEASE, "agent");
            asm volatile("s_waitcnt vmcnt(0)" ::: "memory");
            const unsigned og = xb_add(&bar[XB_TOP], 1u);
            const unsigned tg = og / nx;
            if (og + 1u == (tg + 1u) * nx) xb_add(&bar[XB_TOPGEN], 1u);
            else XB_SPIN(xb_ld(&bar[XB_TOPGEN]) == tg, bar);
            __builtin_amdgcn_fence(__ATOMIC_ACQUIRE, "agent");
            xb_add(&bar[XB_XGEN(b.x)], 1u);
            asm volatile("s_waitcnt vmcnt(0)" ::: "memory");
        } else {
            XB_SPIN(xb_ld(&bar[XB_XGEN(b.x)]) == gen, bar);
            __builtin_amdgcn_fence(__ATOMIC_ACQUIRE, "agent");
            asm volatile("s_waitcnt vmcnt(0)" ::: "memory");
        }
    }
    __syncthreads();
}

struct Params { const float* in[27]; float* out; unsigned char* ws; int ph_lo, ph_hi; };
enum { I_X = 0, I_WIN, I_GMNG, I_GMNB, I_GMWS, I_GMBS, I_CONVW, I_ALOG, I_DTB, I_GDNNG, I_MLIB, I_MLFB, I_MLNG, I_WBR, I_WOUT, I_LN1G, I_LN1B,
       I_WR, I_RB, I_WG, I_WU, I_WD, I_SG, I_SU, I_SD, I_LN2G, I_LN2B };

using pg8::f32x4; using pg8::u32x4; using pg8::Unit; using pg8::HALF; using pg8::BM;

struct EpiMergeH {
    static constexpr bool PERM = true, AFTER_DRAIN = false; static constexpr int MID = MERGE_FP8 ? BW / (2 * pg8::BK) : BW / pg8::BK;
    const bf16* Z; bf16* msum;
    __device__ __forceinline__ void mid(f32x4 (&acc)[2][2][4][2], const Unit& u, int j, int wr, int wc, int fr, int fq) const {
        int row0 = u.pm * BM + wr * 64 + fr; const int col0 = u.pn * BM + wc * 32 + 8 * fq; asm volatile("" : "+v"(row0));
        const bf16* zp = Z + ZC_GATE + (size_t)(j - 1) * D + col0;
#pragma unroll
        for (int am = 0; am < 4; ++am) { const int ai = am >> 1, m0 = (am & 1) * 2; v4u ga[2][2], gb[2][2];
#pragma unroll
            for (int m = 0; m < 2; ++m)
#pragma unroll
                for (int bj = 0; bj < 2; ++bj) { const bf16* q = zp + (size_t)(row0 + ai * HALF + (m0 + m) * 16) * ZC + bj * HALF; ga[m][bj] = *(const v4u*)q; gb[m][bj] = *(const v4u*)(q + D); }
#pragma unroll
            for (int m = 0; m < 2; ++m)
#pragma unroll
                for (int bj = 0; bj < 2; ++bj) { float a[8], b[8]; unpack8(ga[m][bj], a); unpack8(gb[m][bj], b);
#pragma unroll
                    for (int i = 0; i < 8; ++i) { const float ea = __builtin_amdgcn_exp2f(fmaxf(a[i], -60.f) * -1.44269504f), eb = __builtin_amdgcn_exp2f(fmaxf(b[i], -60.f) * -1.44269504f);
                        acc[ai][bj][m0 + m][i >> 2][i & 3] *= (1.f + eb) * __builtin_amdgcn_rcpf(1.f + ea); } }
            asm volatile("" ::: "memory"); }
    }
    __device__ __forceinline__ void operator()(const f32x4 (&acc)[2][2][4][2], const Unit& u, int wr, int wc, int fr, int fq) const {
        const int row0 = u.pm * BM + wr * 64 + fr, col0 = u.pn * BM + wc * 32 + 8 * fq;
#pragma unroll
        for (int ai = 0; ai < 2; ++ai) { v4u gg[4][2];
#pragma unroll
            for (int m = 0; m < 4; ++m)
#pragma unroll
                for (int bj = 0; bj < 2; ++bj) gg[m][bj] = *(const v4u*)(Z + (size_t)(row0 + ai * HALF + m * 16) * ZC + ZC_GATE + 3 * D + col0 + bj * HALF);
#pragma unroll
            for (int m = 0; m < 4; ++m)
#pragma unroll
                for (int bj = 0; bj < 2; ++bj) { const size_t row = (size_t)(row0 + ai * HALF + m * 16); const int col = col0 + bj * HALF; float gl[8]; unpack8(gg[m][bj], gl);
                    f32x4 v0 = acc[ai][bj][m][0], v1 = acc[ai][bj][m][1];
#pragma unroll
                    for (int j = 0; j < 4; ++j) { v0[j] *= sigmoidf_(gl[j]) * MGSC; v1[j] *= sigmoidf_(gl[4 + j]) * MGSC; }
                    unsigned w0 = 0, w1 = 0; w0 = __builtin_amdgcn_cvt_pk_fp8_f32(v0[0], v0[1], w0, false); w0 = __builtin_amdgcn_cvt_pk_fp8_f32(v0[2], v0[3], w0, true); w1 = __builtin_amdgcn_cvt_pk_fp8_f32(v1[0], v1[1], w1, false); w1 = __builtin_amdgcn_cvt_pk_fp8_f32(v1[2], v1[3], w1, true);
                    *(v2u*)((unsigned char*)msum + row * D + col) = (v2u){w0, w1}; }
            asm volatile("" ::: "memory"); }
    }
};
struct EpiResid {
    static constexpr bool PERM = true, AFTER_DRAIN = false; static constexpr int MID = 0;
    const void* X; bf16* Y; float sc; bool xbf;
    __device__ __forceinline__ void operator()(const f32x4 (&acc)[2][2][4][2], const Unit& u, int wr, int wc, int fr, int fq) const {
        const int row0 = u.pm * BM + wr * 64 + fr, col0 = u.pn * BM + wc * 32 + 8 * fq;
#pragma unroll
        for (int ai = 0; ai < 2; ++ai)
#pragma unroll
            for (int m = 0; m < 4; ++m) { const size_t off = (size_t)(row0 + ai * HALF + m * 16) * D + col0;
#pragma unroll
                for (int bj = 0; bj < 2; ++bj) { const f32x4 x0 = ld4(X, off + bj * HALF, xbf), x1 = ld4(X, off + bj * HALF + 4, xbf);
                    const f32x4 v0 = x0 * ALPHA + acc[ai][bj][m][0] * sc, v1 = x1 * ALPHA + acc[ai][bj][m][1] * sc;
                    u32x4 w; w.x = pk2(v0[0], v0[1]); w.y = pk2(v0[2], v0[3]); w.z = pk2(v1[0], v1[1]); w.w = pk2(v1[2], v1[3]); *(u32x4*)(Y + off + bj * HALF) = w; } }
    }
};
struct MoeTab {
    LAS int* t; LAS unsigned short* tok; LAS float* wt; LAS unsigned char* mte;
    __device__ __forceinline__ MoeTab(LAS unsigned char* lds) : t((LAS int*)(lds + TAB_OFF)), tok((LAS unsigned short*)(lds + TAB_OFF + 1024)), wt((LAS float*)(lds + TAB_OFF + 5120)), mte((LAS unsigned char*)(lds + TAB_OFF + 13312)) {}
};
__device__ __forceinline__ void moe_tables(const MoeTab& M, const unsigned* cnt  , int tid, int lane, int wave) {
    __syncthreads();
    if (wave == 0) { const int c = (int)cnt[64 * lane]; const int tiles = (c + 255) >> 8; const float incl = wave_scan_incl((float)tiles);
        M.t[80 + lane] = c; M.t[lane] = (int)incl - tiles; if (lane == 63) { M.t[64] = (int)incl; M.t[65] = (int)incl + T / 256; M.t[80 + 64] = T; } }
    __syncthreads();
    const int Mt = M.t[65];
    for (int mt = tid; mt < Mt; mt += 512) { int e = 0;
        for (int k = 1; k <= 64; ++k) e = (M.t[k] <= mt) ? k : e;
        M.mte[mt] = (unsigned char)e; }
    __syncthreads();
}
struct UpOrder {
    MoeTab M; int n;
    __device__ __forceinline__ bool next(int i, Unit& u) const { if (i >= n) return false; u.pm = M.t[168 + i]; u.pn = M.t[176 + i]; u.aux = i; return true; }
    __device__ __forceinline__ int row_token(int i, int r) const { return (int)M.tok[i * 256 + r]; }
    __device__ __forceinline__ void a_ready(const Unit&) const {}
    __device__ __forceinline__ void done(const Unit&) const {}
};
__device__ __forceinline__ int up_order_build(const MoeTab& M, const int* LIST, const float* WL, int wg, int G, int tid) {
    const int U = 4 * M.t[65];
    if (tid < 8) { const int L = tid * G + wg; if (L < U) { const int mt = L >> 2, q = L & 3, e = M.mte[mt]; M.t[168 + tid] = mt; M.t[176 + tid] = e * 4 + q; M.t[184 + tid] = e; M.t[192 + tid] = mt - M.t[e]; } }
    int n = 0;
#pragma unroll
    for (int i = 0; i < 8; ++i) n += (i * G + wg < U) ? 1 : 0;
    __syncthreads();
    for (int idx = tid; idx < n * 256; idx += 512) { const int i = idx >> 8, r = idx & 255, e = M.t[184 + i], li = M.t[192 + i] * 256 + r;
        int tk = 0; float w = 0.f;
        if (e < NE) { if (li < M.t[80 + e]) { tk = LIST[e * T + li]; w = WL[e * T + li]; } } else { tk = li; w = 1.f; }
        M.tok[idx] = (unsigned short)tk; M.wt[idx] = w; }
    __syncthreads();
    return n;
}
struct EpiGluSparse {
    static constexpr bool PERM = true, AFTER_DRAIN = false; static constexpr int MID = 0;
    LAS const float* wt; bf16* H;
    __device__ __forceinline__ void operator()(const f32x4 (&acc)[2][2][4][2], const Unit& u, int wr, int wc, int fr, int fq) const {
        const int q = u.pn & 3; const int rl0 = wr * 64 + fr, col0 = q * 128 + wc * 32 + 8 * fq;
#pragma unroll
        for (int ai = 0; ai < 2; ++ai)
#pragma unroll
            for (int m = 0; m < 4; ++m) { const int rl = rl0 + ai * HALF + m * 16; const float c = wt[u.aux * 256 + rl]; float h[8];
#pragma unroll
                for (int n = 0; n < 2; ++n)
#pragma unroll
                    for (int j = 0; j < 4; ++j) h[4 * n + j] = siluf_(acc[ai][0][m][n][j] * UPSC) * (acc[ai][1][m][n][j] * UPSC) * c;
#if MOE_DN_FP8
#pragma unroll
                for (int j = 0; j < 8; ++j) h[j] = __builtin_amdgcn_fmed3f(h[j] * HSC, -448.f, 448.f);
                unsigned w0 = 0, w1 = 0; w0 = __builtin_amdgcn_cvt_pk_fp8_f32(h[0], h[1], w0, false); w0 = __builtin_amdgcn_cvt_pk_fp8_f32(h[2], h[3], w0, true); w1 = __builtin_amdgcn_cvt_pk_fp8_f32(h[4], h[5], w1, false); w1 = __builtin_amdgcn_cvt_pk_fp8_f32(h[6], h[7], w1, true);
                *(v2u*)((unsigned char*)H + ((size_t)u.pm * 256 + rl) * ED + col0) = (v2u){w0, w1}; }
#else
                u32x4 w; w.x = pk2(h[0], h[1]); w.y = pk2(h[2], h[3]); w.z = pk2(h[4], h[5]); w.w = pk2(h[6], h[7]);
                *(u32x4*)(H + ((size_t)u.pm * 256 + rl) * ED + col0) = w; }
#endif
    }
};
struct DownOrder {
    MoeTab M; int G, c, U;
    __device__ __forceinline__ bool next(int i, Unit& u) const { const int L = i * G + c; if (L >= U) return false; const int mt = L >> 3; u.pm = mt; u.pn = (int)M.mte[mt] * 8 + (L & 7); u.aux = 0; return true; }
    __device__ __forceinline__ void a_ready(const Unit&) const {}
    __device__ __forceinline__ void done(const Unit&) const {}
};
struct EpiYexp {
    static constexpr bool PERM = true, AFTER_DRAIN = false; static constexpr int MID = 0;
    bf16* Y;
    __device__ __forceinline__ void operator()(const f32x4 (&acc)[2][2][4][2], const Unit& u, int wr, int wc, int fr, int fq) const {
        const int row0 = u.pm * BM + wr * 64 + fr, col0 = (u.pn & 7) * BM + wc * 32 + 8 * fq;
#pragma unroll
        for (int ai = 0; ai < 2; ++ai)
#pragma unroll
            for (int m = 0; m < 4; ++m) { bf16* rowp = Y + (size_t)(row0 + ai * HALF + m * 16) * D + col0;
#pragma unroll
                for (int bj = 0; bj < 2; ++bj) { const f32x4 v0 = acc[ai][bj][m][0] * DNSC, v1 = acc[ai][bj][m][1] * DNSC;
                    u32x4 w; w.x = pk2(v0[0], v0[1]); w.y = pk2(v0[2], v0[3]); w.z = pk2(v1[0], v1[1]); w.w = pk2(v1[2], v1[3]); *(u32x4*)(rowp + bj * HALF) = w; } }
    }
};

struct TrItem { const float* src; bf16* dst; unsigned sld, dld; int f8; };
__device__ __forceinline__ void tr_load(const TrItem& t, int lane, v4f (&v)[8]) { const int r8 = lane >> 3, c4 = lane & 7;
#pragma unroll
    for (int i = 0; i < 8; ++i) v[i] = *(const v4f*)(t.src + (size_t)(8 * i + r8) * t.sld + 4 * c4); }
__device__ __forceinline__ void tr_store(const TrItem& t, const v4f (&v)[8], LAS float* scr, int lane, bool nostore = false) {
    { const int r8 = lane >> 3, c4 = lane & 7;
#pragma unroll
      for (int i = 0; i < 8; ++i) { LAS float* d = scr + (8 * i + r8) * 33 + 4 * c4; d[0] = v[i].x; d[1] = v[i].y; d[2] = v[i].z; d[3] = v[i].w; } }
    LDS_WAIT(); asm volatile("" ::: "memory");
    if (nostore) return;
    if (t.f8) {
        const int c = lane & 3;
#pragma unroll
        for (int j = 0; j < 2; ++j) { const int n = (lane >> 2) + 16 * j; const LAS float* s = scr + (16 * c) * 33 + n; unsigned w[4];
#pragma unroll
            for (int q = 0; q < 4; ++q) { unsigned x = 0; x = __builtin_amdgcn_cvt_pk_fp8_f32(s[(4 * q) * 33] * 64.f, s[(4 * q + 1) * 33] * 64.f, x, false); x = __builtin_amdgcn_cvt_pk_fp8_f32(s[(4 * q + 2) * 33] * 64.f, s[(4 * q + 3) * 33] * 64.f, x, true); w[q] = x; }
            *(v4u*)((unsigned char*)t.dst + (size_t)n * t.dld + 16 * c) = (v4u){w[0], w[1], w[2], w[3]}; }
    } else {
        const int c = lane & 7;
#pragma unroll
        for (int j = 0; j < 4; ++j) { const int n = (lane >> 3) + 8 * j; const LAS float* s = scr + (8 * c) * 33 + n;
            v4u o; o.x = pk2(s[0 * 33], s[1 * 33]); o.y = pk2(s[2 * 33], s[3 * 33]); o.z = pk2(s[4 * 33], s[5 * 33]); o.w = pk2(s[6 * 33], s[7 * 33]);
            *(v4u*)(t.dst + (size_t)n * t.dld + 8 * c) = o; }
    }
    LDS_WAIT(); asm volatile("" ::: "memory");
}
template <int PART> __device__ __forceinline__ TrItem tr_decode(const Params& p, int l, int it) {
    unsigned char* ws = p.ws;
    constexpr int N_IN = (ZC / 32) * (D / 64), N_BR = 4 * (BW / 64) * (D / 32), N_OUT = (D / 64) * (D / 32), N_UP = NEX * 2 * (D / 64) * (ED / 32);
    int r = it; TrItem t; t.f8 = 0;
    if (PART == 0) {
        const float* w_in = p.in[I_WIN] + (size_t)l * D * INC; const float* w_br = p.in[I_WBR] + (size_t)l * 4 * BW * D; const float* w_out = p.in[I_WOUT] + (size_t)l * D * D;
        bf16* WIN = (bf16*)(ws + WS_WIN); bf16* WBR = (bf16*)(ws + WS_WBR); bf16* WOUT = (bf16*)(ws + WS_WOUT);
        if (r < N_IN) { const int kb = r / (ZC / 32), n0 = (r % (ZC / 32)) * 32, k0 = kb * 64; const int sc = n0 + (n0 >= ZC_GATE ? 16 : (n0 >= ZC_MLQ ? 8 : 0));
            t.src = w_in + (size_t)k0 * INC + sc; t.sld = INC; t.dst = (bf16*)((unsigned char*)WIN + (size_t)n0 * D + k0); t.dld = D; t.f8 = 1; return t; } r -= N_IN;
        if (r < N_BR) { const int g = r / 512, rr = r % 512, k0 = (rr / 64) * 64, n0 = (rr % 64) * 32;
            t.src = w_br + ((size_t)g * BW + k0) * D + n0; t.sld = D;
#if MERGE_FP8
            t.dst = (bf16*)((unsigned char*)WBR + (size_t)n0 * BRW + g * BW + k0); t.dld = BRW; t.f8 = 1; return t; }
#else
            t.dst = WBR + (size_t)n0 * BRW + g * BW + k0; t.dld = BRW; return t; }
#endif
        r -= N_BR;
        { const int k0 = (r / 64) * 64, n0 = (r % 64) * 32; t.src = w_out + (size_t)k0 * D + n0; t.sld = D; t.dst = (bf16*)((unsigned char*)WOUT + (size_t)n0 * D + k0); t.dld = D; t.f8 = 1; return t; }
    } else {
        const float* w_g = p.in[I_WG] + (size_t)l * NE * D * ED; const float* w_u = p.in[I_WU] + (size_t)l * NE * D * ED; const float* w_d = p.in[I_WD] + (size_t)l * NE * ED * D;
        const float* s_g = p.in[I_SG] + (size_t)l * D * ED; const float* s_u = p.in[I_SU] + (size_t)l * D * ED; const float* s_d = p.in[I_SD] + (size_t)l * ED * D;
        bf16* WUP = (bf16*)(ws + WS_WUP); bf16* WDN = (bf16*)(ws + WS_WDN);
        if (r < N_UP) { const int e = r / 1024, rr = r % 1024, mat = rr / 512, r2 = rr % 512, k0 = (r2 / 16) * 64, n0 = (r2 % 16) * 32;
            const float* sb = (e < NE) ? ((mat ? w_u : w_g) + (size_t)e * D * ED) : (mat ? s_u : s_g);
            const int drow = e * 1024 + (n0 / 128) * 256 + mat * 128 + (n0 % 128);
            t.src = sb + (size_t)k0 * ED + n0; t.sld = ED;
#if MOE_UP_FP8
            t.dst = (bf16*)((unsigned char*)WUP + (size_t)drow * D + k0); t.dld = D; t.f8 = 1; return t; }
#else
            t.dst = WUP + (size_t)drow * D + k0; t.dld = D; return t; }
#endif
        r -= N_UP;
        { const int e = r / 512, rr = r % 512, k0 = (rr / 64) * 64, n0 = (rr % 64) * 32;
            const float* sb = (e < NE) ? (w_d + (size_t)e * ED * D) : s_d;
            t.src = sb + (size_t)k0 * D + n0; t.sld = D;
#if MOE_DN_FP8
            t.dst = (bf16*)((unsigned char*)WDN + ((size_t)e * D + n0) * ED + k0); t.dld = ED; t.f8 = 1; return t; }
#else
            t.dst = WDN + ((size_t)e * D + n0) * ED + k0; t.dld = ED; return t; }
#endif
    }
}
template <int PART> __device__ __forceinline__ void phase_convert(const Params& p, int l, LAS unsigned char* lds, int gw, int NGW, int wave, int lane, bool nostore = false) {
    constexpr int N_IN = (ZC / 32) * (D / 64), N_BR = 4 * (BW / 64) * (D / 32), N_OUT = (D / 64) * (D / 32), N_UP = NEX * 2 * (D / 64) * (ED / 32), N_DN = NEX * (ED / 64) * (D / 32);
    constexpr int NITEMS = (PART == 0) ? (N_IN + N_BR + N_OUT) : (N_UP + N_DN);
    LAS float* scr = (LAS float*)(lds + wave * 16384);
    if (gw >= NITEMS) return;
    TrItem cur = tr_decode<PART>(p, l, gw); v4f va[8], vb[8];
    tr_load(cur, lane, va);
    for (int it = gw; it < NITEMS; it += 2 * NGW) {
        const int i1 = it + NGW, i2 = it + 2 * NGW; TrItem nx = cur;
        if (i1 < NITEMS) { nx = tr_decode<PART>(p, l, i1); } tr_load(nx, lane, vb);
        tr_store(cur, va, scr, lane, nostore);
        if (i1 >= NITEMS) break;
        cur = nx; if (i2 < NITEMS) { cur = tr_decode<PART>(p, l, i2); } tr_load(cur, lane, va);
        tr_store(nx, vb, scr, lane, nostore);
        if (i2 >= NITEMS) break;
    }
}
__device__ __forceinline__ void phase_xprep(const Params& p, int l, const void* xin, bool xbf, LAS unsigned char* lds, int gw, int NGW, int tid, int lane) {
    const float* w_in = p.in[I_WIN] + (size_t)l * D * INC;
    constexpr int XP = 2052; LAS float* xt = (LAS float*)lds; LAS float* part = (LAS float*)lds;
    const int wave = tid >> 6, n_l = lane & 15, kq = lane >> 4, wg = gw >> 3, G = NGW >> 3;
    const int colw = n_l < 8 ? 4608 + n_l : 6152 + (n_l - 8);
    float bw[64];
#pragma unroll
    for (int q = 0; q < 64; ++q) bw[q] = w_in[(size_t)(256 * wave + 16 * (q >> 2) + 4 * kq + (q & 3)) * INC + colw];
    unsigned char* XB = p.ws + WS_XB; float* SMALL = (float*)(p.ws + WS_SMALL);
    __syncthreads();
    for (int tg = wg; tg < T / 16; tg += G) {
        {   v4f va[8], vb[8]; const size_t m0 = (size_t)tg * 16 + 2 * wave;
#pragma unroll
            for (int j = 0; j < 8; ++j) { va[j] = ld4(xin, m0 * D + 4 * lane + 256 * j, xbf); vb[j] = ld4(xin, (m0 + 1) * D + 4 * lane + 256 * j, xbf); }
#pragma unroll
            for (int rr = 0; rr < 2; ++rr) { unsigned* xo = (unsigned*)(XB + (m0 + rr) * D) + lane;
#pragma unroll
                for (int j = 0; j < 8; ++j) { const v4f v = rr ? vb[j] : va[j]; unsigned w = 0; w = __builtin_amdgcn_cvt_pk_fp8_f32(v.x, v.y, w, false); w = __builtin_amdgcn_cvt_pk_fp8_f32(v.z, v.w, w, true); xo[64 * j] = w;
                    *(LAS v4f*)(xt + (2 * wave + rr) * XP + 4 * lane + 256 * j) = v; } } }
        __syncthreads();
        {   pg8::f32x4 acc[4];
#pragma unroll
            for (int i = 0; i < 4; ++i) acc[i] = (pg8::f32x4){0.f, 0.f, 0.f, 0.f};
            const LAS float* xa = xt + n_l * XP + 256 * wave + 4 * kq;
#pragma unroll
            for (int s2 = 0; s2 < 16; ++s2) { const v4f a4 = *(const LAS v4f*)(xa + 16 * s2);
                acc[0] = __builtin_amdgcn_mfma_f32_16x16x4f32(a4.x, bw[4 * s2 + 0], acc[0], 0, 0, 0); acc[1] = __builtin_amdgcn_mfma_f32_16x16x4f32(a4.y, bw[4 * s2 + 1], acc[1], 0, 0, 0);
                acc[2] = __builtin_amdgcn_mfma_f32_16x16x4f32(a4.z, bw[4 * s2 + 2], acc[2], 0, 0, 0); acc[3] = __builtin_amdgcn_mfma_f32_16x16x4f32(a4.w, bw[4 * s2 + 3], acc[3], 0, 0, 0); }
            const pg8::f32x4 tot = (acc[0] + acc[1]) + (acc[2] + acc[3]);
            __syncthreads();
#pragma unroll
            for (int j = 0; j < 4; ++j) part[(wave * 16 + 4 * kq + j) * 16 + n_l] = tot[j]; }
        __syncthreads();
        if (tid < 256) { float a = 0.f;
#pragma unroll
            for (int w = 0; w < 8; ++w) a += part[w * 256 + tid];
            SMALL[(size_t)tg * 256 + tid] = a; }
        __syncthreads();
    }
}


typedef short bf16x8_t __attribute__((ext_vector_type(8)));
__device__ __forceinline__ void ml_pre_item(const Params& p, int l, LAS unsigned char* lds, int item, int tid, int wave, int lane) {
    const int h = item & 3, n = item >> 2; const size_t t0 = (size_t)n * 64;
    const bf16* Z = (const bf16*)(p.ws + WS_Z); const float* SMALL = (const float*)(p.ws + WS_SMALL);
    bf16* MQ = (bf16*)(p.ws + WS_MQ) + (size_t)item * 4096; bf16* MS = (bf16*)(p.ws + WS_MS) + (size_t)item * 4096; bf16* MK = (bf16*)(p.ws + WS_MK) + (size_t)item * 4096;
    bf16* MV = (bf16*)(p.ws + WS_MV) + (size_t)item * 9216; float* MFL = (float*)(p.ws + WS_MFL);
    LAS float* qs = (LAS float*)lds;
    LAS float* ks = qs + 64 * 65;
    LAS float* bs = ks + 64 * 65;
    LAS unsigned short* vs = (LAS unsigned short*)(bs + 128);
    { const int tk = tid >> 3, c8 = tid & 7; float f[8];
      unpack8(*(const v4u*)(Z + (t0 + tk) * ZC + ZC_MLQ + h * 64 + 8 * c8), f);
#pragma unroll
      for (int i = 0; i < 8; ++i) qs[tk * 65 + 8 * c8 + i] = f[i];
      unpack8(*(const v4u*)(Z + (t0 + tk) * ZC + ZC_MLK + h * 64 + 8 * c8), f);
#pragma unroll
      for (int i = 0; i < 8; ++i) ks[tk * 65 + 8 * c8 + i] = f[i]; }
#pragma unroll
    for (int r = 0; r < 2; ++r) { const int idx = tid + 512 * r, tk = idx >> 4, c8 = idx & 15;
        *(LAS v4u*)(vs + tk * 136 + 8 * c8) = *(const v4u*)(Z + (t0 + tk) * ZC + ZC_MLV + h * 128 + 8 * c8); }
    if (wave == 0) { const float fp = SMALL[(t0 + lane) * 16 + 12 + h] + p.in[I_MLFB][l * 4 + h]; const float lf = -softplusf_(-fp);
        bs[lane] = wave_scan_incl(lf); bs[64 + lane] = SMALL[(t0 + lane) * 16 + 8 + h] + p.in[I_MLIB][l * 4 + h]; }
    __syncthreads();
    const float blast = bs[63];
    { const int i = tid >> 3, jb = tid & 7; const float bi = bs[i];
      { const float e = __expf(bi) * 0.125f; float o[8];
#pragma unroll
        for (int x = 0; x < 8; ++x) o[x] = qs[i * 65 + 8 * jb + x] * e;
        v4u w; w.x = pk2(o[0], o[1]); w.y = pk2(o[2], o[3]); w.z = pk2(o[4], o[5]); w.w = pk2(o[6], o[7]); *(v4u*)(MQ + i * 64 + 8 * jb) = w; }
      {
          const int ti = wave >> 1, c16 = lane & 15, g4 = lane >> 4, i2 = 16 * ti + c16; const float bi2 = bs[i2];
#define ML_F8(dst, base) do { const LAS float* _b = (base); const v4u _w = (v4u){pg8::cvt_pk_bf16(_b[0], _b[1]), pg8::cvt_pk_bf16(_b[2], _b[3]), pg8::cvt_pk_bf16(_b[4], _b[5]), pg8::cvt_pk_bf16(_b[6], _b[7])}; dst = __builtin_bit_cast(bf16x8_t, _w); } while (0)
          bf16x8_t bq[2];
#pragma unroll
          for (int s2 = 0; s2 < 2; ++s2) ML_F8(bq[s2], qs + i2 * 65 + 32 * s2 + 8 * g4);
#pragma unroll
          for (int jj = 0; jj < 2; ++jj) { const int tj = 2 * (wave & 1) + jj; v2u sw = (v2u){0u, 0u};
              if (tj <= ti) { pg8::f32x4 d = {0.f, 0.f, 0.f, 0.f};
#pragma unroll
                  for (int s2 = 0; s2 < 2; ++s2) { bf16x8_t a; ML_F8(a, ks + (16 * tj + c16) * 65 + 32 * s2 + 8 * g4); d = __builtin_amdgcn_mfma_f32_16x16x32_bf16(a, bq[s2], d, 0, 0, 0); }
                  float v4[4];
#pragma unroll
                  for (int r = 0; r < 4; ++r) { const int j = 16 * tj + 4 * g4 + r; v4[r] = (j <= i2) ? __expf(bi2 - bs[j] + bs[64 + j]) * d[r] * 0.125f : 0.f; }
                  sw = (v2u){pk2(v4[0], v4[1]), pk2(v4[2], v4[3])}; }
              *(v2u*)(MS + i2 * 64 + 16 * tj + 4 * g4) = sw; }
#undef ML_F8
      }
      { float o[8];
#pragma unroll
        for (int x = 0; x < 8; ++x) { const int j = 8 * jb + x; o[x] = ks[j * 65 + i] * __expf(blast - bs[j] + bs[64 + j]); }
        v4u w; w.x = pk2(o[0], o[1]); w.y = pk2(o[2], o[3]); w.z = pk2(o[4], o[5]); w.w = pk2(o[6], o[7]); *(v4u*)(MK + i * 64 + 8 * jb) = w; }
    }
    { const int c = tid >> 2, jq = tid & 3; unsigned w[8];
#pragma unroll
      for (int x = 0; x < 8; ++x) w[x] = (unsigned)vs[(16 * jq + 2 * x) * 136 + c] | ((unsigned)vs[(16 * jq + 2 * x + 1) * 136 + c] << 16);
      *(v4u*)(MV + c * 64 + 16 * jq) = (v4u){w[0], w[1], w[2], w[3]}; *(v4u*)(MV + c * 64 + 16 * jq + 8) = (v4u){w[4], w[5], w[6], w[7]};
      if (tid < 64) { const int c2 = 128 + (tid >> 2); const unsigned one = (c2 == 128) ? 0x3F803F80u : 0u;
          *(v4u*)(MV + c2 * 64 + 16 * jq) = (v4u){one, one, one, one}; *(v4u*)(MV + c2 * 64 + 16 * jq + 8) = (v4u){one, one, one, one}; } }
    if (tid == 0) MFL[item] = __expf(blast);
    __syncthreads();
}
struct MlFrags { bf16x8_t q[2], s[2], kt[2], vt[2]; float fl; };
__device__ __forceinline__ void ml_load(MlFrags& F, const Params& p, int item, int offA, int offV) {
    const bf16* MQ = (const bf16*)(p.ws + WS_MQ) + (size_t)item * 4096; const bf16* MS = (const bf16*)(p.ws + WS_MS) + (size_t)item * 4096; const bf16* MK = (const bf16*)(p.ws + WS_MK) + (size_t)item * 4096;
    const bf16* MV = (const bf16*)(p.ws + WS_MV) + (size_t)item * 9216;
#pragma unroll
    for (int ks = 0; ks < 2; ++ks) { F.q[ks] = *(const bf16x8_t*)(MQ + offA + 32 * ks); F.s[ks] = *(const bf16x8_t*)(MS + offA + 32 * ks); F.kt[ks] = *(const bf16x8_t*)(MK + offA + 32 * ks); F.vt[ks] = *(const bf16x8_t*)(MV + offV + 32 * ks); }
    F.fl = ((const float*)(p.ws + WS_MFL))[item];
}
__device__ __forceinline__ void ml_seq(const Params& p, LAS unsigned char* lds, int wgi, int wave, int lane) {
    const int u = wgi * 2 + (wave >> 2), wi = wave & 3, h = u / 9, sl = u % 9, g = lane >> 4, c = lane & 15;
    LAS unsigned short* CT = (LAS unsigned short*)(lds + (wave >> 2) * 4096);
    float* HO = (float*)(p.ws + WS_HO); float* HDEN = (float*)(p.ws + WS_HDEN);
    const int offA = (16 * wi + c) * 64 + 8 * g, offV = (16 * sl + c) * 64 + 8 * g;
    *(LAS v2u*)(CT + c * 64 + 16 * wi + 4 * g) = (v2u){0u, 0u};
    pg8::f32x4 Cacc = {0.f, 0.f, 0.f, 0.f};
    __syncthreads();
    MlFrags F0, F1;
    ml_load(F0, p, h, offA, offV);
#define ML_STEP(F, n_) do { const int cur = (n_) & 1; \
        const bf16x8_t c0 = *(const LAS bf16x8_t*)(CT + cur * 1024 + c * 64 + 8 * g), c1 = *(const LAS bf16x8_t*)(CT + cur * 1024 + c * 64 + 32 + 8 * g); \
        pg8::f32x4 num = {0.f, 0.f, 0.f, 0.f}; \
        num = __builtin_amdgcn_mfma_f32_16x16x32_bf16(F.q[0], c0, num, 0, 0, 0); num = __builtin_amdgcn_mfma_f32_16x16x32_bf16(F.q[1], c1, num, 0, 0, 0); \
        num = __builtin_amdgcn_mfma_f32_16x16x32_bf16(F.s[0], F.vt[0], num, 0, 0, 0); num = __builtin_amdgcn_mfma_f32_16x16x32_bf16(F.s[1], F.vt[1], num, 0, 0, 0); \
        Cacc = Cacc * F.fl; \
        Cacc = __builtin_amdgcn_mfma_f32_16x16x32_bf16(F.kt[0], F.vt[0], Cacc, 0, 0, 0); Cacc = __builtin_amdgcn_mfma_f32_16x16x32_bf16(F.kt[1], F.vt[1], Cacc, 0, 0, 0); \
        { v2u w; w.x = pk2(Cacc[0], Cacc[1]); w.y = pk2(Cacc[2], Cacc[3]); *(LAS v2u*)(CT + (cur ^ 1) * 1024 + c * 64 + 16 * wi + 4 * g) = w; } \
        { const size_t tb = (size_t)(n_) * 64 + 16 * wi + 4 * g; \
          if (sl < 8) { _Pragma("unroll") for (int r = 0; r < 4; ++r) HO[(tb + r) * BW + h * 128 + 16 * sl + c] = num[r]; } \
          else if (c == 0) { _Pragma("unroll") for (int r = 0; r < 4; ++r) HDEN[(tb + r) * 4 + h] = num[r]; } } \
        LDS_BAR(); } while (0)
    for (int n = 0; n < T / 64; n += 2) {
        ml_load(F1, p, (n + 1) * 4 + h, offA, offV);
        ML_STEP(F0, n);
        ml_load(F0, p, ((n + 2 < T / 64) ? n + 2 : n) * 4 + h, offA, offV);
        ML_STEP(F1, n + 1);
    }
#undef ML_STEP
}


constexpr int QP = 132;
__device__ __forceinline__ void gdn_pre_item(const Params& p, int l, LAS unsigned char* lds, int item, int tid, int wave, int lane) {
    const int h = item & 3, n = item >> 2; const size_t t0 = (size_t)n * 64;
    const bf16* Z = (const bf16*)(p.ws + WS_Z); const float* SMALL = (const float*)(p.ws + WS_SMALL);
    float* GU = (float*)(p.ws + WS_GU) + (size_t)item * 8192; bf16* GNW = (bf16*)(p.ws + WS_GNW) + (size_t)item * 8192; bf16* GQG = (bf16*)(p.ws + WS_GQG) + (size_t)item * 8192;
    bf16* GAT = (bf16*)(p.ws + WS_GAT) + (size_t)item * 4096; bf16* GKT = (bf16*)(p.ws + WS_GKT) + (size_t)item * 8192; float* GDL = (float*)(p.ws + WS_GDL);
    const float* cw = p.in[I_CONVW] + (size_t)l * 4 * 1536;
    LAS float* qs = (LAS float*)lds; LAS float* ks = qs + 64 * QP; LAS float* vs = ks + 64 * QP; LAS float* Ls = vs + 64 * QP;   LAS float* gcs = Ls + 64 * 68; LAS float* bts = gcs + 64; LAS float* btg = bts + 64;
    { const int tk = tid >> 3, part = tid & 7;
#pragma unroll 1
      for (int i = 0; i < 3; ++i) { float a[16];
#pragma unroll
        for (int x = 0; x < 16; ++x) a[x] = 0.f;
#pragma unroll
        for (int j = 0; j < 4; ++j) { const long tt = (long)t0 + tk - 3 + j; if (tt >= 0) {
            const bf16* src = Z + (size_t)tt * ZC + ZC_GDN + i * 512 + h * 128 + 16 * part; float x0[8], x1[8]; unpack8(*(const v4u*)src, x0); unpack8(*(const v4u*)(src + 8), x1);
            const float* wp = cw + j * 1536 + i * 512 + h * 128 + 16 * part;
#pragma unroll
            for (int x = 0; x < 8; ++x) { a[x] += wp[x] * x0[x]; a[8 + x] += wp[8 + x] * x1[x]; } } }
        float ss = 0.f;
#pragma unroll
        for (int x = 0; x < 16; ++x) { a[x] = siluf_(a[x]); ss += a[x] * a[x]; }
        if (i < 2) { ss = sum8(ss); const float r = rsqrtf(ss + 1e-6f) * (i == 0 ? 0.08838834764831845f : 1.f);
#pragma unroll
            for (int x = 0; x < 16; ++x) a[x] *= r; }
        LAS float* dst = (i == 0 ? qs : (i == 1 ? ks : vs)) + tk * QP + 16 * part;
#pragma unroll
        for (int x4 = 0; x4 < 4; ++x4) *(LAS v4f*)(dst + 4 * x4) = (v4f){a[4 * x4], a[4 * x4 + 1], a[4 * x4 + 2], a[4 * x4 + 3]}; } }
    if (wave == 0) { const float bb = SMALL[(t0 + lane) * 16 + h], aa = SMALL[(t0 + lane) * 16 + 4 + h];
        const float g = -__expf(p.in[I_ALOG][l * 4 + h]) * softplusf_(aa + p.in[I_DTB][l * 4 + h]);
        const float gc = wave_scan_incl(g), bt = sigmoidf_(bb); gcs[lane] = gc; bts[lane] = bt; btg[lane] = bt * __expf(gc); }
    __syncthreads();
    { const int ti = wave >> 1, c16 = lane & 15, g4 = lane >> 4, i = 16 * ti + c16; const float gi = gcs[i], bi = bts[i];
#define GDN_F8(dst, base) do { const v4f _a = *(const LAS v4f*)(base), _b = *(const LAS v4f*)((base) + 4); const v4u _w = (v4u){pg8::cvt_pk_bf16(_a.x, _a.y), pg8::cvt_pk_bf16(_a.z, _a.w), pg8::cvt_pk_bf16(_b.x, _b.y), pg8::cvt_pk_bf16(_b.z, _b.w)}; dst = __builtin_bit_cast(bf16x8_t, _w); } while (0)
      bf16x8_t bk[4], bq[4];
#pragma unroll
      for (int s4 = 0; s4 < 4; ++s4) { GDN_F8(bk[s4], ks + i * QP + 32 * s4 + 8 * g4); GDN_F8(bq[s4], qs + i * QP + 32 * s4 + 8 * g4); }
#pragma unroll
      for (int jj = 0; jj < 2; ++jj) { const int tj = 2 * (wave & 1) + jj; v4f lv = (v4f){0.f, 0.f, 0.f, 0.f}; v2u aw = (v2u){0u, 0u};
          if (tj <= ti) { pg8::f32x4 dk = {0.f, 0.f, 0.f, 0.f}, dq = {0.f, 0.f, 0.f, 0.f};
#pragma unroll
              for (int s4 = 0; s4 < 4; ++s4) { bf16x8_t a; GDN_F8(a, ks + (16 * tj + c16) * QP + 32 * s4 + 8 * g4);
                  dk = __builtin_amdgcn_mfma_f32_16x16x32_bf16(a, bk[s4], dk, 0, 0, 0); dq = __builtin_amdgcn_mfma_f32_16x16x32_bf16(a, bq[s4], dq, 0, 0, 0); }
              float l4[4], a4[4];
#pragma unroll
              for (int r = 0; r < 4; ++r) { const int j = 16 * tj + 4 * g4 + r; const float dc = __expf(gi - gcs[j]); l4[r] = (j < i) ? bi * dk[r] * dc : 0.f; a4[r] = (j <= i) ? dq[r] * dc : 0.f; }
              lv = (v4f){l4[0], l4[1], l4[2], l4[3]}; aw = (v2u){pk2(a4[0], a4[1]), pk2(a4[2], a4[3])}; }
          *(LAS v4f*)(Ls + i * 68 + 16 * tj + 4 * g4) = lv; *(v2u*)(GAT + i * 64 + 16 * tj + 4 * g4) = aw; }
#undef GDN_F8
    }
    __syncthreads();
    if (tid < 256) {
        const int c = tid; int vz; asm volatile("v_mov_b32 %0, 0" : "=v"(vz));
        const LAS float* rp = (c < 128) ? (vs + c) : (ks + (c - 128)); const LAS float* mp = ((c < 128) ? bts : btg) + vz;
#define GDN_RHS(i) (rp[(i) * QP] * mp[(i)])
#define GDN_L4(i, j4) (*(const LAS v4f*)(Ls + (i) * 68 + 4 * (j4) + vz))
        float x0 = GDN_RHS(0); __builtin_amdgcn_sched_barrier(0);
        float x1 = GDN_RHS(1); { const v4f l = GDN_L4(1, 0); x1 -= l.x * x0; } __builtin_amdgcn_sched_barrier(0);
        float x2 = GDN_RHS(2); { const v4f l = GDN_L4(2, 0); x2 -= l.x * x0; x2 -= l.y * x1; } __builtin_amdgcn_sched_barrier(0);
        float x3 = GDN_RHS(3); { const v4f l = GDN_L4(3, 0); x3 -= l.x * x0; x3 -= l.y * x1; x3 -= l.z * x2; } __builtin_amdgcn_sched_barrier(0);
        float x4 = GDN_RHS(4); { const v4f l = GDN_L4(4, 0); x4 -= l.x * x0; x4 -= l.y * x1; x4 -= l.z * x2; x4 -= l.w * x3; } __builtin_amdgcn_sched_barrier(0);
        float x5 = GDN_RHS(5); { const v4f l = GDN_L4(5, 0); x5 -= l.x * x0; x5 -= l.y * x1; x5 -= l.z * x2; x5 -= l.w * x3; } { const v4f l = GDN_L4(5, 1); x5 -= l.x * x4; } __builtin_amdgcn_sched_barrier(0);
        float x6 = GDN_RHS(6); { const v4f l = GDN_L4(6, 0); x6 -= l.x * x0; x6 -= l.y * x1; x6 -= l.z * x2; x6 -= l.w * x3; } { const v4f l = GDN_L4(6, 1); x6 -= l.x * x4; x6 -= l.y * x5; } __builtin_amdgcn_sched_barrier(0);
        float x7 = GDN_RHS(7); { const v4f l = GDN_L4(7, 0); x7 -= l.x * x0; x7 -= l.y * x1; x7 -= l.z * x2; x7 -= l.w * x3; } { const v4f l = GDN_L4(7, 1); x7 -= l.x * x4; x7 -= l.y * x5; x7 -= l.z * x6; } __builtin_amdgcn_sched_barrier(0);
        float x8 = GDN_RHS(8); { const v4f l = GDN_L4(8, 0); x8 -= l.x * x0; x8 -= l.y * x1; x8 -= l.z * x2; x8 -= l.w * x3; } { const v4f l = GDN_L4(8, 1); x8 -= l.x * x4; x8 -= l.y * x5; x8 -= l.z * x6; x8 -= l.w * x7; } __builtin_amdgcn_sched_barrier(0);
        float x9 = GDN_RHS(9); { const v4f l = GDN_L4(9, 0); x9 -= l.x * x0; x9 -= l.y * x1; x9 -= l.z * x2; x9 -= l.w * x3; } { const v4f l = GDN_L4(9, 1); x9 -= l.x * x4; x9 -= l.y * x5; x9 -= l.z * x6; x9 -= l.w * x7; } { const v4f l = GDN_L4(9, 2); x9 -= l.x * x8; } __builtin_amdgcn_sched_barrier(0);
        float x10 = GDN_RHS(10); { const v4f l = GDN_L4(10, 0); x10 -= l.x * x0; x10 -= l.y * x1; x10 -= l.z * x2; x10 -= l.w * x3; } { const v4f l = GDN_L4(10, 1); x10 -= l.x * x4; x10 -= l.y * x5; x10 -= l.z * x6; x10 -= l.w * x7; } { const v4f l = GDN_L4(10, 2); x10 -= l.x * x8; x10 -= l.y * x9; } __builtin_amdgcn_sched_barrier(0);
        float x11 = GDN_RHS(11); { const v4f l = GDN_L4(11, 0); x11 -= l.x * x0; x11 -= l.y * x1; x11 -= l.z * x2; x11 -= l.w * x3; } { const v4f l = GDN_L4(11, 1); x11 -= l.x * x4; x11 -= l.y * x5; x11 -= l.z * x6; x11 -= l.w * x7; } { const v4f l = GDN_L4(11, 2); x11 -= l.x * x8; x11 -= l.y * x9; x11 -= l.z * x10; } __builtin_amdgcn_sched_barrier(0);
        float x12 = GDN_RHS(12); { const v4f l = GDN_L4(12, 0); x12 -= l.x * x0; x12 -= l.y * x1; x12 -= l.z * x2; x12 -= l.w * x3; } { const v4f l = GDN_L4(12, 1); x12 -= l.x * x4; x12 -= l.y * x5; x12 -= l.z * x6; x12 -= l.w * x7; } { const v4f l = GDN_L4(12, 2); x12 -= l.x * x8; x12 -= l.y * x9; x12 -= l.z * x10; x12 -= l.w * x11; } __builtin_amdgcn_sched_barrier(0);
        float x13 = GDN_RHS(13); { const v4f l = GDN_L4(13, 0); x13 -= l.x * x0; x13 -= l.y * x1; x13 -= l.z * x2; x13 -= l.w * x3; } { const v4f l = GDN_L4(13, 1); x13 -= l.x * x4; x13 -= l.y * x5; x13 -= l.z * x6; x13 -= l.w * x7; } { const v4f l = GDN_L4(13, 2); x13 -= l.x * x8; x13 -= l.y * x9; x13 -= l.z * x10; x13 -= l.w * x11; } { const v4f l = GDN_L4(13, 3); x13 -= l.x * x12; } __builtin_amdgcn_sched_barrier(0);
        float x14 = GDN_RHS(14); { const v4f l = GDN_L4(14, 0); x14 -= l.x * x0; x14 -= l.y * x1; x14 -= l.z * x2; x14 -= l.w * x3; } { const v4f l = GDN_L4(14, 1); x14 -= l.x * x4; x14 -= l.y * x5; x14 -= l.z * x6; x14 -= l.w * x7; } { const v4f l = GDN_L4(14, 2); x14 -= l.x * x8; x14 -= l.y * x9; x14 -= l.z * x10; x14 -= l.w * x11; } { const v4f l = GDN_L4(14, 3); x14 -= l.x * x12; x14 -= l.y * x13; } __builtin_amdgcn_sched_barrier(0);
        float x15 = GDN_RHS(15); { const v4f l = GDN_L4(15, 0); x15 -= l.x * x0; x15 -= l.y * x1; x15 -= l.z * x2; x15 -= l.w * x3; } { const v4f l = GDN_L4(15, 1); x15 -= l.x * x4; x15 -= l.y * x5; x15 -= l.z * x6; x15 -= l.w * x7; } { const v4f l = GDN_L4(15, 2); x15 -= l.x * x8; x15 -= l.y * x9; x15 -= l.z * x10; x15 -= l.w * x11; } { const v4f l = GDN_L4(15, 3); x15 -= l.x * x12; x15 -= l.y * x13; x15 -= l.z * x14; } __builtin_amdgcn_sched_barrier(0);
        float x16 = GDN_RHS(16); { const v4f l = GDN_L4(16, 0); x16 -= l.x * x0; x16 -= l.y * x1; x16 -= l.z * x2; x16 -= l.w * x3; } { const v4f l = GDN_L4(16, 1); x16 -= l.x * x4; x16 -= l.y * x5; x16 -= l.z * x6; x16 -= l.w * x7; } { const v4f l = GDN_L4(16, 2); x16 -= l.x * x8; x16 -= l.y * x9; x16 -= l.z * x10; x16 -= l.w * x11; } { const v4f l = GDN_L4(16, 3); x16 -= l.x * x12; x16 -= l.y * x13; x16 -= l.z * x14; x16 -= l.w * x15; } __builtin_amdgcn_sched_barrier(0);
        float x17 = GDN_RHS(17); { const v4f l = GDN_L4(17, 0); x17 -= l.x * x0; x17 -= l.y * x1; x17 -= l.z * x2; x17 -= l.w * x3; } { const v4f l = GDN_L4(17, 1); x17 -= l.x * x4; x17 -= l.y * x5; x17 -= l.z * x6; x17 -= l.w * x7; } { const v4f l = GDN_L4(17, 2); x17 -= l.x * x8; x17 -= l.y * x9; x17 -= l.z * x10; x17 -= l.w * x11; } { const v4f l = GDN_L4(17, 3); x17 -= l.x * x12; x17 -= l.y * x13; x17 -= l.z * x14; x17 -= l.w * x15; } { const v4f l = GDN_L4(17, 4); x17 -= l.x * x16; } __builtin_amdgcn_sched_barrier(0);
        float x18 = GDN_RHS(18); { const v4f l = GDN_L4(18, 0); x18 -= l.x * x0; x18 -= l.y * x1; x18 -= l.z * x2; x18 -= l.w * x3; } { const v4f l = GDN_L4(18, 1); x18 -= l.x * x4; x18 -= l.y * x5; x18 -= l.z * x6; x18 -= l.w * x7; } { const v4f l = GDN_L4(18, 2); x18 -= l.x * x8; x18 -= l.y * x9; x18 -= l.z * x10; x18 -= l.w * x11; } { const v4f l = GDN_L4(18, 3); x18 -= l.x * x12; x18 -= l.y * x13; x18 -= l.z * x14; x18 -= l.w * x15; } { const v4f l = GDN_L4(18, 4); x18 -= l.x * x16; x18 -= l.y * x17; } __builtin_amdgcn_sched_barrier(0);
        float x19 = GDN_RHS(19); { const v4f l = GDN_L4(19, 0); x19 -= l.x * x0; x19 -= l.y * x1; x19 -= l.z * x2; x19 -= l.w * x3; } { const v4f l = GDN_L4(19, 1); x19 -= l.x * x4; x19 -= l.y * x5; x19 -= l.z * x6; x19 -= l.w * x7; } { const v4f l = GDN_L4(19, 2); x19 -= l.x * x8; x19 -= l.y * x9; x19 -= l.z * x10; x19 -= l.w * x11; } { const v4f l = GDN_L4(19, 3); x19 -= l.x * x12; x19 -= l.y * x13; x19 -= l.z * x14; x19 -= l.w * x15; } { const v4f l = GDN_L4(19, 4); x19 -= l.x * x16; x19 -= l.y * x17; x19 -= l.z * x18; } __builtin_amdgcn_sched_barrier(0);
        float x20 = GDN_RHS(20); { const v4f l = GDN_L4(20, 0); x20 -= l.x * x0; x20 -= l.y * x1; x20 -= l.z * x2; x20 -= l.w * x3; } { const v4f l = GDN_L4(20, 1); x20 -= l.x * x4; x20 -= l.y * x5; x20 -= l.z * x6; x20 -= l.w * x7; } { const v4f l = GDN_L4(20, 2); x20 -= l.x * x8; x20 -= l.y * x9; x20 -= l.z * x10; x20 -= l.w * x11; } { const v4f l = GDN_L4(20, 3); x20 -= l.x * x12; x20 -= l.y * x13; x20 -= l.z * x14; x20 -= l.w * x15; } { const v4f l = GDN_L4(20, 4); x20 -= l.x * x16; x20 -= l.y * x17; x20 -= l.z * x18; x20 -= l.w * x19; } __builtin_amdgcn_sched_barrier(0);
        float x21 = GDN_RHS(21); { const v4f l = GDN_L4(21, 0); x21 -= l.x * x0; x21 -= l.y * x1; x21 -= l.z * x2; x21 -= l.w * x3; } { const v4f l = GDN_L4(21, 1); x21 -= l.x * x4; x21 -= l.y * x5; x21 -= l.z * x6; x21 -= l.w * x7; } { const v4f l = GDN_L4(21, 2); x21 -= l.x * x8; x21 -= l.y * x9; x21 -= l.z * x10; x21 -= l.w * x11; } { const v4f l = GDN_L4(21, 3); x21 -= l.x * x12; x21 -= l.y * x13; x21 -= l.z * x14; x21 -= l.w * x15; } { const v4f l = GDN_L4(21, 4); x21 -= l.x * x16; x21 -= l.y * x17; x21 -= l.z * x18; x21 -= l.w * x19; } { const v4f l = GDN_L4(21, 5); x21 -= l.x * x20; } __builtin_amdgcn_sched_barrier(0);
        float x22 = GDN_RHS(22); { const v4f l = GDN_L4(22, 0); x22 -= l.x * x0; x22 -= l.y * x1; x22 -= l.z * x2; x22 -= l.w * x3; } { const v4f l = GDN_L4(22, 1); x22 -= l.x * x4; x22 -= l.y * x5; x22 -= l.z * x6; x22 -= l.w * x7; } { const v4f l = GDN_L4(22, 2); x22 -= l.x * x8; x22 -= l.y * x9; x22 -= l.z * x10; x22 -= l.w * x11; } { const v4f l = GDN_L4(22, 3); x22 -= l.x * x12; x22 -= l.y * x13; x22 -= l.z * x14; x22 -= l.w * x15; } { const v4f l = GDN_L4(22, 4); x22 -= l.x * x16; x22 -= l.y * x17; x22 -= l.z * x18; x22 -= l.w * x19; } { const v4f l = GDN_L4(22, 5); x22 -= l.x * x20; x22 -= l.y * x21; } __builtin_amdgcn_sched_barrier(0);
        float x23 = GDN_RHS(23); { const v4f l = GDN_L4(23, 0); x23 -= l.x * x0; x23 -= l.y * x1; x23 -= l.z * x2; x23 -= l.w * x3; } { const v4f l = GDN_L4(23, 1); x23 -= l.x * x4; x23 -= l.y * x5; x23 -= l.z * x6; x23 -= l.w * x7; } { const v4f l = GDN_L4(23, 2); x23 -= l.x * x8; x23 -= l.y * x9; x23 -= l.z * x10; x23 -= l.w * x11; } { const v4f l = GDN_L4(23, 3); x23 -= l.x * x12; x23 -= l.y * x13; x23 -= l.z * x14; x23 -= l.w * x15; } { const v4f l = GDN_L4(23, 4); x23 -= l.x * x16; x23 -= l.y * x17; x23 -= l.z * x18; x23 -= l.w * x19; } { const v4f l = GDN_L4(23, 5); x23 -= l.x * x20; x23 -= l.y * x21; x23 -= l.z * x22; } __builtin_amdgcn_sched_barrier(0);
        float x24 = GDN_RHS(24); { const v4f l = GDN_L4(24, 0); x24 -= l.x * x0; x24 -= l.y * x1; x24 -= l.z * x2; x24 -= l.w * x3; } { const v4f l = GDN_L4(24, 1); x24 -= l.x * x4; x24 -= l.y * x5; x24 -= l.z * x6; x24 -= l.w * x7; } { const v4f l = GDN_L4(24, 2); x24 -= l.x * x8; x24 -= l.y * x9; x24 -= l.z * x10; x24 -= l.w * x11; } { const v4f l = GDN_L4(24, 3); x24 -= l.x * x12; x24 -= l.y * x13; x24 -= l.z * x14; x24 -= l.w * x15; } { const v4f l = GDN_L4(24, 4); x24 -= l.x * x16; x24 -= l.y * x17; x24 -= l.z * x18; x24 -= l.w * x19; } { const v4f l = GDN_L4(24, 5); x24 -= l.x * x20; x24 -= l.y * x21; x24 -= l.z * x22; x24 -= l.w * x23; } __builtin_amdgcn_sched_barrier(0);
        float x25 = GDN_RHS(25); { const v4f l = GDN_L4(25, 0); x25 -= l.x * x0; x25 -= l.y * x1; x25 -= l.z * x2; x25 -= l.w * x3; } { const v4f l = GDN_L4(25, 1); x25 -= l.x * x4; x25 -= l.y * x5; x25 -= l.z * x6; x25 -= l.w * x7; } { const v4f l = GDN_L4(25, 2); x25 -= l.x * x8; x25 -= l.y * x9; x25 -= l.z * x10; x25 -= l.w * x11; } { const v4f l = GDN_L4(25, 3); x25 -= l.x * x12; x25 -= l.y * x13; x25 -= l.z * x14; x25 -= l.w * x15; } { const v4f l = GDN_L4(25, 4); x25 -= l.x * x16; x25 -= l.y * x17; x25 -= l.z * x18; x25 -= l.w * x19; } { const v4f l = GDN_L4(25, 5); x25 -= l.x * x20; x25 -= l.y * x21; x25 -= l.z * x22; x25 -= l.w * x23; } { const v4f l = GDN_L4(25, 6); x25 -= l.x * x24; } __builtin_amdgcn_sched_barrier(0);
        float x26 = GDN_RHS(26); { const v4f l = GDN_L4(26, 0); x26 -= l.x * x0; x26 -= l.y * x1; x26 -= l.z * x2; x26 -= l.w * x3; } { const v4f l = GDN_L4(26, 1); x26 -= l.x * x4; x26 -= l.y * x5; x26 -= l.z * x6; x26 -= l.w * x7; } { const v4f l = GDN_L4(26, 2); x26 -= l.x * x8; x26 -= l.y * x9; x26 -= l.z * x10; x26 -= l.w * x11; } { const v4f l = GDN_L4(26, 3); x26 -= l.x * x12; x26 -= l.y * x13; x26 -= l.z * x14; x26 -= l.w * x15; } { const v4f l = GDN_L4(26, 4); x26 -= l.x * x16; x26 -= l.y * x17; x26 -= l.z * x18; x26 -= l.w * x19; } { const v4f l = GDN_L4(26, 5); x26 -= l.x * x20; x26 -= l.y * x21; x26 -= l.z * x22; x26 -= l.w * x23; } { const v4f l = GDN_L4(26, 6); x26 -= l.x * x24; x26 -= l.y * x25; } __builtin_amdgcn_sched_barrier(0);
        float x27 = GDN_RHS(27); { const v4f l = GDN_L4(27, 0); x27 -= l.x * x0; x27 -= l.y * x1; x27 -= l.z * x2; x27 -= l.w * x3; } { const v4f l = GDN_L4(27, 1); x27 -= l.x * x4; x27 -= l.y * x5; x27 -= l.z * x6; x27 -= l.w * x7; } { const v4f l = GDN_L4(27, 2); x27 -= l.x * x8; x27 -= l.y * x9; x27 -= l.z * x10; x27 -= l.w * x11; } { const v4f l = GDN_L4(27, 3); x27 -= l.x * x12; x27 -= l.y * x13; x27 -= l.z * x14; x27 -= l.w * x15; } { const v4f l = GDN_L4(27, 4); x27 -= l.x * x16; x27 -= l.y * x17; x27 -= l.z * x18; x27 -= l.w * x19; } { const v4f l = GDN_L4(27, 5); x27 -= l.x * x20; x27 -= l.y * x21; x27 -= l.z * x22; x27 -= l.w * x23; } { const v4f l = GDN_L4(27, 6); x27 -= l.x * x24; x27 -= l.y * x25; x27 -= l.z * x26; } __builtin_amdgcn_sched_barrier(0);
        float x28 = GDN_RHS(28); { const v4f l = GDN_L4(28, 0); x28 -= l.x * x0; x28 -= l.y * x1; x28 -= l.z * x2; x28 -= l.w * x3; } { const v4f l = GDN_L4(28, 1); x28 -= l.x * x4; x28 -= l.y * x5; x28 -= l.z * x6; x28 -= l.w * x7; } { const v4f l = GDN_L4(28, 2); x28 -= l.x * x8; x28 -= l.y * x9; x28 -= l.z * x10; x28 -= l.w * x11; } { const v4f l = GDN_L4(28, 3); x28 -= l.x * x12; x28 -= l.y * x13; x28 -= l.z * x14; x28 -= l.w * x15; } { const v4f l = GDN_L4(28, 4); x28 -= l.x * x16; x28 -= l.y * x17; x28 -= l.z * x18; x28 -= l.w * x19; } { const v4f l = GDN_L4(28, 5); x28 -= l.x * x20; x28 -= l.y * x21; x28 -= l.z * x22; x28 -= l.w * x23; } { const v4f l = GDN_L4(28, 6); x28 -= l.x * x24; x28 -= l.y * x25; x28 -= l.z * x26; x28 -= l.w * x27; } __builtin_amdgcn_sched_barrier(0);
        float x29 = GDN_RHS(29); { const v4f l = GDN_L4(29, 0); x29 -= l.x * x0; x29 -= l.y * x1; x29 -= l.z * x2; x29 -= l.w * x3; } { const v4f l = GDN_L4(29, 1); x29 -= l.x * x4; x29 -= l.y * x5; x29 -= l.z * x6; x29 -= l.w * x7; } { const v4f l = GDN_L4(29, 2); x29 -= l.x * x8; x29 -= l.y * x9; x29 -= l.z * x10; x29 -= l.w * x11; } { const v4f l = GDN_L4(29, 3); x29 -= l.x * x12; x29 -= l.y * x13; x29 -= l.z * x14; x29 -= l.w * x15; } { const v4f l = GDN_L4(29, 4); x29 -= l.x * x16; x29 -= l.y * x17; x29 -= l.z * x18; x29 -= l.w * x19; } { const v4f l = GDN_L4(29, 5); x29 -= l.x * x20; x29 -= l.y * x21; x29 -= l.z * x22; x29 -= l.w * x23; } { const v4f l = GDN_L4(29, 6); x29 -= l.x * x24; x29 -= l.y * x25; x29 -= l.z * x26; x29 -= l.w * x27; } { const v4f l = GDN_L4(29, 7); x29 -= l.x * x28; } __builtin_amdgcn_sched_barrier(0);
        float x30 = GDN_RHS(30); { const v4f l = GDN_L4(30, 0); x30 -= l.x * x0; x30 -= l.y * x1; x30 -= l.z * x2; x30 -= l.w * x3; } { const v4f l = GDN_L4(30, 1); x30 -= l.x * x4; x30 -= l.y * x5; x30 -= l.z * x6; x30 -= l.w * x7; } { const v4f l = GDN_L4(30, 2); x30 -= l.x * x8; x30 -= l.y * x9; x30 -= l.z * x10; x30 -= l.w * x11; } { const v4f l = GDN_L4(30, 3); x30 -= l.x * x12; x30 -= l.y * x13; x30 -= l.z * x14; x30 -= l.w * x15; } { const v4f l = GDN_L4(30, 4); x30 -= l.x * x16; x30 -= l.y * x17; x30 -= l.z * x18; x30 -= l.w * x19; } { const v4f l = GDN_L4(30, 5); x30 -= l.x * x20; x30 -= l.y * x21; x30 -= l.z * x22; x30 -= l.w * x23; } { const v4f l = GDN_L4(30, 6); x30 -= l.x * x24; x30 -= l.y * x25; x30 -= l.z * x26; x30 -= l.w * x27; } { const v4f l = GDN_L4(30, 7); x30 -= l.x * x28; x30 -= l.y * x29; } __builtin_amdgcn_sched_barrier(0);
        float x31 = GDN_RHS(31); { const v4f l = GDN_L4(31, 0); x31 -= l.x * x0; x31 -= l.y * x1; x31 -= l.z * x2; x31 -= l.w * x3; } { const v4f l = GDN_L4(31, 1); x31 -= l.x * x4; x31 -= l.y * x5; x31 -= l.z * x6; x31 -= l.w * x7; } { const v4f l = GDN_L4(31, 2); x31 -= l.x * x8; x31 -= l.y * x9; x31 -= l.z * x10; x31 -= l.w * x11; } { const v4f l = GDN_L4(31, 3); x31 -= l.x * x12; x31 -= l.y * x13; x31 -= l.z * x14; x31 -= l.w * x15; } { const v4f l = GDN_L4(31, 4); x31 -= l.x * x16; x31 -= l.y * x17; x31 -= l.z * x18; x31 -= l.w * x19; } { const v4f l = GDN_L4(31, 5); x31 -= l.x * x20; x31 -= l.y * x21; x31 -= l.z * x22; x31 -= l.w * x23; } { const v4f l = GDN_L4(31, 6); x31 -= l.x * x24; x31 -= l.y * x25; x31 -= l.z * x26; x31 -= l.w * x27; } { const v4f l = GDN_L4(31, 7); x31 -= l.x * x28; x31 -= l.y * x29; x31 -= l.z * x30; } __builtin_amdgcn_sched_barrier(0);
        float x32 = GDN_RHS(32); { const v4f l = GDN_L4(32, 0); x32 -= l.x * x0; x32 -= l.y * x1; x32 -= l.z * x2; x32 -= l.w * x3; } { const v4f l = GDN_L4(32, 1); x32 -= l.x * x4; x32 -= l.y * x5; x32 -= l.z * x6; x32 -= l.w * x7; } { const v4f l = GDN_L4(32, 2); x32 -= l.x * x8; x32 -= l.y * x9; x32 -= l.z * x10; x32 -= l.w * x11; } { const v4f l = GDN_L4(32, 3); x32 -= l.x * x12; x32 -= l.y * x13; x32 -= l.z * x14; x32 -= l.w * x15; } { const v4f l = GDN_L4(32, 4); x32 -= l.x * x16; x32 -= l.y * x17; x32 -= l.z * x18; x32 -= l.w * x19; } { const v4f l = GDN_L4(32, 5); x32 -= l.x * x20; x32 -= l.y * x21; x32 -= l.z * x22; x32 -= l.w * x23; } { const v4f l = GDN_L4(32, 6); x32 -= l.x * x24; x32 -= l.y * x25; x32 -= l.z * x26; x32 -= l.w * x27; } { const v4f l = GDN_L4(32, 7); x32 -= l.x * x28; x32 -= l.y * x29; x32 -= l.z * x30; x32 -= l.w * x31; } __builtin_amdgcn_sched_barrier(0);
        float x33 = GDN_RHS(33); { const v4f l = GDN_L4(33, 0); x33 -= l.x * x0; x33 -= l.y * x1; x33 -= l.z * x2; x33 -= l.w * x3; } { const v4f l = GDN_L4(33, 1); x33 -= l.x * x4; x33 -= l.y * x5; x33 -= l.z * x6; x33 -= l.w * x7; } { const v4f l = GDN_L4(33, 2); x33 -= l.x * x8; x33 -= l.y * x9; x33 -= l.z * x10; x33 -= l.w * x11; } { const v4f l = GDN_L4(33, 3); x33 -= l.x * x12; x33 -= l.y * x13; x33 -= l.z * x14; x33 -= l.w * x15; } { const v4f l = GDN_L4(33, 4); x33 -= l.x * x16; x33 -= l.y * x17; x33 -= l.z * x18; x33 -= l.w * x19; } { const v4f l = GDN_L4(33, 5); x33 -= l.x * x20; x33 -= l.y * x21; x33 -= l.z * x22; x33 -= l.w * x23; } { const v4f l = GDN_L4(33, 6); x33 -= l.x * x24; x33 -= l.y * x25; x33 -= l.z * x26; x33 -= l.w * x27; } { const v4f l = GDN_L4(33, 7); x33 -= l.x * x28; x33 -= l.y * x29; x33 -= l.z * x30; x33 -= l.w * x31; } { const v4f l = GDN_L4(33, 8); x33 -= l.x * x32; } __builtin_amdgcn_sched_barrier(0);
        float x34 = GDN_RHS(34); { const v4f l = GDN_L4(34, 0); x34 -= l.x * x0; x34 -= l.y * x1; x34 -= l.z * x2; x34 -= l.w * x3; } { const v4f l = GDN_L4(34, 1); x34 -= l.x * x4; x34 -= l.y * x5; x34 -= l.z * x6; x34 -= l.w * x7; } { const v4f l = GDN_L4(34, 2); x34 -= l.x * x8; x34 -= l.y * x9; x34 -= l.z * x10; x34 -= l.w * x11; } { const v4f l = GDN_L4(34, 3); x34 -= l.x * x12; x34 -= l.y * x13; x34 -= l.z * x14; x34 -= l.w * x15; } { const v4f l = GDN_L4(34, 4); x34 -= l.x * x16; x34 -= l.y * x17; x34 -= l.z * x18; x34 -= l.w * x19; } { const v4f l = GDN_L4(34, 5); x34 -= l.x * x20; x34 -= l.y * x21; x34 -= l.z * x22; x34 -= l.w * x23; } { const v4f l = GDN_L4(34, 6); x34 -= l.x * x24; x34 -= l.y * x25; x34 -= l.z * x26; x34 -= l.w * x27; } { const v4f l = GDN_L4(34, 7); x34 -= l.x * x28; x34 -= l.y * x29; x34 -= l.z * x30; x34 -= l.w * x31; } { const v4f l = GDN_L4(34, 8); x34 -= l.x * x32; x34 -= l.y * x33; } __builtin_amdgcn_sched_barrier(0);
        float x35 = GDN_RHS(35); { const v4f l = GDN_L4(35, 0); x35 -= l.x * x0; x35 -= l.y * x1; x35 -= l.z * x2; x35 -= l.w * x3; } { const v4f l = GDN_L4(35, 1); x35 -= l.x * x4; x35 -= l.y * x5; x35 -= l.z * x6; x35 -= l.w * x7; } { const v4f l = GDN_L4(35, 2); x35 -= l.x * x8; x35 -= l.y * x9; x35 -= l.z * x10; x35 -= l.w * x11; } { const v4f l = GDN_L4(35, 3); x35 -= l.x * x12; x35 -= l.y * x13; x35 -= l.z * x14; x35 -= l.w * x15; } { const v4f l = GDN_L4(35, 4); x35 -= l.x * x16; x35 -= l.y * x17; x35 -= l.z * x18; x35 -= l.w * x19; } { const v4f l = GDN_L4(35, 5); x35 -= l.x * x20; x35 -= l.y * x21; x35 -= l.z * x22; x35 -= l.w * x23; } { const v4f l = GDN_L4(35, 6); x35 -= l.x * x24; x35 -= l.y * x25; x35 -= l.z * x26; x35 -= l.w * x27; } { const v4f l = GDN_L4(35, 7); x35 -= l.x * x28; x35 -= l.y * x29; x35 -= l.z * x30; x35 -= l.w * x31; } { const v4f l = GDN_L4(35, 8); x35 -= l.x * x32; x35 -= l.y * x33; x35 -= l.z * x34; } __builtin_amdgcn_sched_barrier(0);
        float x36 = GDN_RHS(36); { const v4f l = GDN_L4(36, 0); x36 -= l.x * x0; x36 -= l.y * x1; x36 -= l.z * x2; x36 -= l.w * x3; } { const v4f l = GDN_L4(36, 1); x36 -= l.x * x4; x36 -= l.y * x5; x36 -= l.z * x6; x36 -= l.w * x7; } { const v4f l = GDN_L4(36, 2); x36 -= l.x * x8; x36 -= l.y * x9; x36 -= l.z * x10; x36 -= l.w * x11; } { const v4f l = GDN_L4(36, 3); x36 -= l.x * x12; x36 -= l.y * x13; x36 -= l.z * x14; x36 -= l.w * x15; } { const v4f l = GDN_L4(36, 4); x36 -= l.x * x16; x36 -= l.y * x17; x36 -= l.z * x18; x36 -= l.w * x19; } { const v4f l = GDN_L4(36, 5); x36 -= l.x * x20; x36 -= l.y * x21; x36 -= l.z * x22; x36 -= l.w * x23; } { const v4f l = GDN_L4(36, 6); x36 -= l.x * x24; x36 -= l.y * x25; x36 -= l.z * x26; x36 -= l.w * x27; } { const v4f l = GDN_L4(36, 7); x36 -= l.x * x28; x36 -= l.y * x29; x36 -= l.z * x30; x36 -= l.w * x31; } { const v4f l = GDN_L4(36, 8); x36 -= l.x * x32; x36 -= l.y * x33; x36 -= l.z * x34; x36 -= l.w * x35; } __builtin_amdgcn_sched_barrier(0);
        float x37 = GDN_RHS(37); { const v4f l = GDN_L4(37, 0); x37 -= l.x * x0; x37 -= l.y * x1; x37 -= l.z * x2; x37 -= l.w * x3; } { const v4f l = GDN_L4(37, 1); x37 -= l.x * x4; x37 -= l.y * x5; x37 -= l.z * x6; x37 -= l.w * x7; } { const v4f l = GDN_L4(37, 2); x37 -= l.x * x8; x37 -= l.y * x9; x37 -= l.z * x10; x37 -= l.w * x11; } { const v4f l = GDN_L4(37, 3); x37 -= l.x * x12; x37 -= l.y * x13; x37 -= l.z * x14; x37 -= l.w * x15; } { const v4f l = GDN_L4(37, 4); x37 -= l.x * x16; x37 -= l.y * x17; x37 -= l.z * x18; x37 -= l.w * x19; } { const v4f l = GDN_L4(37, 5); x37 -= l.x * x20; x37 -= l.y * x21; x37 -= l.z * x22; x37 -= l.w * x23; } { const v4f l = GDN_L4(37, 6); x37 -= l.x * x24; x37 -= l.y * x25; x37 -= l.z * x26; x37 -= l.w * x27; } { const v4f l = GDN_L4(37, 7); x37 -= l.x * x28; x37 -= l.y * x29; x37 -= l.z * x30; x37 -= l.w * x31; } { const v4f l = GDN_L4(37, 8); x37 -= l.x * x32; x37 -= l.y * x33; x37 -= l.z * x34; x37 -= l.w * x35; } { const v4f l = GDN_L4(37, 9); x37 -= l.x * x36; } __builtin_amdgcn_sched_barrier(0);
        float x38 = GDN_RHS(38); { const v4f l = GDN_L4(38, 0); x38 -= l.x * x0; x38 -= l.y * x1; x38 -= l.z * x2; x38 -= l.w * x3; } { const v4f l = GDN_L4(38, 1); x38 -= l.x * x4; x38 -= l.y * x5; x38 -= l.z * x6; x38 -= l.w * x7; } { const v4f l = GDN_L4(38, 2); x38 -= l.x * x8; x38 -= l.y * x9; x38 -= l.z * x10; x38 -= l.w * x11; } { const v4f l = GDN_L4(38, 3); x38 -= l.x * x12; x38 -= l.y * x13; x38 -= l.z * x14; x38 -= l.w * x15; } { const v4f l = GDN_L4(38, 4); x38 -= l.x * x16; x38 -= l.y * x17; x38 -= l.z * x18; x38 -= l.w * x19; } { const v4f l = GDN_L4(38, 5); x38 -= l.x * x20; x38 -= l.y * x21; x38 -= l.z * x22; x38 -= l.w * x23; } { const v4f l = GDN_L4(38, 6); x38 -= l.x * x24; x38 -= l.y * x25; x38 -= l.z * x26; x38 -= l.w * x27; } { const v4f l = GDN_L4(38, 7); x38 -= l.x * x28; x38 -= l.y * x29; x38 -= l.z * x30; x38 -= l.w * x31; } { const v4f l = GDN_L4(38, 8); x38 -= l.x * x32; x38 -= l.y * x33; x38 -= l.z * x34; x38 -= l.w * x35; } { const v4f l = GDN_L4(38, 9); x38 -= l.x * x36; x38 -= l.y * x37; } __builtin_amdgcn_sched_barrier(0);
        float x39 = GDN_RHS(39); { const v4f l = GDN_L4(39, 0); x39 -= l.x * x0; x39 -= l.y * x1; x39 -= l.z * x2; x39 -= l.w * x3; } { const v4f l = GDN_L4(39, 1); x39 -= l.x * x4; x39 -= l.y * x5; x39 -= l.z * x6; x39 -= l.w * x7; } { const v4f l = GDN_L4(39, 2); x39 -= l.x * x8; x39 -= l.y * x9; x39 -= l.z * x10; x39 -= l.w * x11; } { const v4f l = GDN_L4(39, 3); x39 -= l.x * x12; x39 -= l.y * x13; x39 -= l.z * x14; x39 -= l.w * x15; } { const v4f l = GDN_L4(39, 4); x39 -= l.x * x16; x39 -= l.y * x17; x39 -= l.z * x18; x39 -= l.w * x19; } { const v4f l = GDN_L4(39, 5); x39 -= l.x * x20; x39 -= l.y * x21; x39 -= l.z * x22; x39 -= l.w * x23; } { const v4f l = GDN_L4(39, 6); x39 -= l.x * x24; x39 -= l.y * x25; x39 -= l.z * x26; x39 -= l.w * x27; } { const v4f l = GDN_L4(39, 7); x39 -= l.x * x28; x39 -= l.y * x29; x39 -= l.z * x30; x39 -= l.w * x31; } { const v4f l = GDN_L4(39, 8); x39 -= l.x * x32; x39 -= l.y * x33; x39 -= l.z * x34; x39 -= l.w * x35; } { const v4f l = GDN_L4(39, 9); x39 -= l.x * x36; x39 -= l.y * x37; x39 -= l.z * x38; } __builtin_amdgcn_sched_barrier(0);
        float x40 = GDN_RHS(40); { const v4f l = GDN_L4(40, 0); x40 -= l.x * x0; x40 -= l.y * x1; x40 -= l.z * x2; x40 -= l.w * x3; } { const v4f l = GDN_L4(40, 1); x40 -= l.x * x4; x40 -= l.y * x5; x40 -= l.z * x6; x40 -= l.w * x7; } { const v4f l = GDN_L4(40, 2); x40 -= l.x * x8; x40 -= l.y * x9; x40 -= l.z * x10; x40 -= l.w * x11; } { const v4f l = GDN_L4(40, 3); x40 -= l.x * x12; x40 -= l.y * x13; x40 -= l.z * x14; x40 -= l.w * x15; } { const v4f l = GDN_L4(40, 4); x40 -= l.x * x16; x40 -= l.y * x17; x40 -= l.z * x18; x40 -= l.w * x19; } { const v4f l = GDN_L4(40, 5); x40 -= l.x * x20; x40 -= l.y * x21; x40 -= l.z * x22; x40 -= l.w * x23; } { const v4f l = GDN_L4(40, 6); x40 -= l.x * x24; x40 -= l.y * x25; x40 -= l.z * x26; x40 -= l.w * x27; } { const v4f l = GDN_L4(40, 7); x40 -= l.x * x28; x40 -= l.y * x29; x40 -= l.z * x30; x40 -= l.w * x31; } { const v4f l = GDN_L4(40, 8); x40 -= l.x * x32; x40 -= l.y * x33; x40 -= l.z * x34; x40 -= l.w * x35; } { const v4f l = GDN_L4(40, 9); x40 -= l.x * x36; x40 -= l.y * x37; x40 -= l.z * x38; x40 -= l.w * x39; } __builtin_amdgcn_sched_barrier(0);
        float x41 = GDN_RHS(41); { const v4f l = GDN_L4(41, 0); x41 -= l.x * x0; x41 -= l.y * x1; x41 -= l.z * x2; x41 -= l.w * x3; } { const v4f l = GDN_L4(41, 1); x41 -= l.x * x4; x41 -= l.y * x5; x41 -= l.z * x6; x41 -= l.w * x7; } { const v4f l = GDN_L4(41, 2); x41 -= l.x * x8; x41 -= l.y * x9; x41 -= l.z * x10; x41 -= l.w * x11; } { const v4f l = GDN_L4(41, 3); x41 -= l.x * x12; x41 -= l.y * x13; x41 -= l.z * x14; x41 -= l.w * x15; } { const v4f l = GDN_L4(41, 4); x41 -= l.x * x16; x41 -= l.y * x17; x41 -= l.z * x18; x41 -= l.w * x19; } { const v4f l = GDN_L4(41, 5); x41 -= l.x * x20; x41 -= l.y * x21; x41 -= l.z * x22; x41 -= l.w * x23; } { const v4f l = GDN_L4(41, 6); x41 -= l.x * x24; x41 -= l.y * x25; x41 -= l.z * x26; x41 -= l.w * x27; } { const v4f l = GDN_L4(41, 7); x41 -= l.x * x28; x41 -= l.y * x29; x41 -= l.z * x30; x41 -= l.w * x31; } { const v4f l = GDN_L4(41, 8); x41 -= l.x * x32; x41 -= l.y * x33; x41 -= l.z * x34; x41 -= l.w * x35; } { const v4f l = GDN_L4(41, 9); x41 -= l.x * x36; x41 -= l.y * x37; x41 -= l.z * x38; x41 -= l.w * x39; } { const v4f l = GDN_L4(41, 10); x41 -= l.x * x40; } __builtin_amdgcn_sched_barrier(0);
        float x42 = GDN_RHS(42); { const v4f l = GDN_L4(42, 0); x42 -= l.x * x0; x42 -= l.y * x1; x42 -= l.z * x2; x42 -= l.w * x3; } { const v4f l = GDN_L4(42, 1); x42 -= l.x * x4; x42 -= l.y * x5; x42 -= l.z * x6; x42 -= l.w * x7; } { const v4f l = GDN_L4(42, 2); x42 -= l.x * x8; x42 -= l.y * x9; x42 -= l.z * x10; x42 -= l.w * x11; } { const v4f l = GDN_L4(42, 3); x42 -= l.x * x12; x42 -= l.y * x13; x42 -= l.z * x14; x42 -= l.w * x15; } { const v4f l = GDN_L4(42, 4); x42 -= l.x * x16; x42 -= l.y * x17; x42 -= l.z * x18; x42 -= l.w * x19; } { const v4f l = GDN_L4(42, 5); x42 -= l.x * x20; x42 -= l.y * x21; x42 -= l.z * x22; x42 -= l.w * x23; } { const v4f l = GDN_L4(42, 6); x42 -= l.x * x24; x42 -= l.y * x25; x42 -= l.z * x26; x42 -= l.w * x27; } { const v4f l = GDN_L4(42, 7); x42 -= l.x * x28; x42 -= l.y * x29; x42 -= l.z * x30; x42 -= l.w * x31; } { const v4f l = GDN_L4(42, 8); x42 -= l.x * x32; x42 -= l.y * x33; x42 -= l.z * x34; x42 -= l.w * x35; } { const v4f l = GDN_L4(42, 9); x42 -= l.x * x36; x42 -= l.y * x37; x42 -= l.z * x38; x42 -= l.w * x39; } { const v4f l = GDN_L4(42, 10); x42 -= l.x * x40; x42 -= l.y * x41; } __builtin_amdgcn_sched_barrier(0);
        float x43 = GDN_RHS(43); { const v4f l = GDN_L4(43, 0); x43 -= l.x * x0; x43 -= l.y * x1; x43 -= l.z * x2; x43 -= l.w * x3; } { const v4f l = GDN_L4(43, 1); x43 -= l.x * x4; x43 -= l.y * x5; x43 -= l.z * x6; x43 -= l.w * x7; } { const v4f l = GDN_L4(43, 2); x43 -= l.x * x8; x43 -= l.y * x9; x43 -= l.z * x10; x43 -= l.w * x11; } { const v4f l = GDN_L4(43, 3); x43 -= l.x * x12; x43 -= l.y * x13; x43 -= l.z * x14; x43 -= l.w * x15; } { const v4f l = GDN_L4(43, 4); x43 -= l.x * x16; x43 -= l.y * x17; x43 -= l.z * x18; x43 -= l.w * x19; } { const v4f l = GDN_L4(43, 5); x43 -= l.x * x20; x43 -= l.y * x21; x43 -= l.z * x22; x43 -= l.w * x23; } { const v4f l = GDN_L4(43, 6); x43 -= l.x * x24; x43 -= l.y * x25; x43 -= l.z * x26; x43 -= l.w * x27; } { const v4f l = GDN_L4(43, 7); x43 -= l.x * x28; x43 -= l.y * x29; x43 -= l.z * x30; x43 -= l.w * x31; } { const v4f l = GDN_L4(43, 8); x43 -= l.x * x32; x43 -= l.y * x33; x43 -= l.z * x34; x43 -= l.w * x35; } { const v4f l = GDN_L4(43, 9); x43 -= l.x * x36; x43 -= l.y * x37; x43 -= l.z * x38; x43 -= l.w * x39; } { const v4f l = GDN_L4(43, 10); x43 -= l.x * x40; x43 -= l.y * x41; x43 -= l.z * x42; } __builtin_amdgcn_sched_barrier(0);
        float x44 = GDN_RHS(44); { const v4f l = GDN_L4(44, 0); x44 -= l.x * x0; x44 -= l.y * x1; x44 -= l.z * x2; x44 -= l.w * x3; } { const v4f l = GDN_L4(44, 1); x44 -= l.x * x4; x44 -= l.y * x5; x44 -= l.z * x6; x44 -= l.w * x7; } { const v4f l = GDN_L4(44, 2); x44 -= l.x * x8; x44 -= l.y * x9; x44 -= l.z * x10; x44 -= l.w * x11; } { const v4f l = GDN_L4(44, 3); x44 -= l.x * x12; x44 -= l.y * x13; x44 -= l.z * x14; x44 -= l.w * x15; } { const v4f l = GDN_L4(44, 4); x44 -= l.x * x16; x44 -= l.y * x17; x44 -= l.z * x18; x44 -= l.w * x19; } { const v4f l = GDN_L4(44, 5); x44 -= l.x * x20; x44 -= l.y * x21; x44 -= l.z * x22; x44 -= l.w * x23; } { const v4f l = GDN_L4(44, 6); x44 -= l.x * x24; x44 -= l.y * x25; x44 -= l.z * x26; x44 -= l.w * x27; } { const v4f l = GDN_L4(44, 7); x44 -= l.x * x28; x44 -= l.y * x29; x44 -= l.z * x30; x44 -= l.w * x31; } { const v4f l = GDN_L4(44, 8); x44 -= l.x * x32; x44 -= l.y * x33; x44 -= l.z * x34; x44 -= l.w * x35; } { const v4f l = GDN_L4(44, 9); x44 -= l.x * x36; x44 -= l.y * x37; x44 -= l.z * x38; x44 -= l.w * x39; } { const v4f l = GDN_L4(44, 10); x44 -= l.x * x40; x44 -= l.y * x41; x44 -= l.z * x42; x44 -= l.w * x43; } __builtin_amdgcn_sched_barrier(0);
        float x45 = GDN_RHS(45); { const v4f l = GDN_L4(45, 0); x45 -= l.x * x0; x45 -= l.y * x1; x45 -= l.z * x2; x45 -= l.w * x3; } { const v4f l = GDN_L4(45, 1); x45 -= l.x * x4; x45 -= l.y * x5; x45 -= l.z * x6; x45 -= l.w * x7; } { const v4f l = GDN_L4(45, 2); x45 -= l.x * x8; x45 -= l.y * x9; x45 -= l.z * x10; x45 -= l.w * x11; } { const v4f l = GDN_L4(45, 3); x45 -= l.x * x12; x45 -= l.y * x13; x45 -= l.z * x14; x45 -= l.w * x15; } { const v4f l = GDN_L4(45, 4); x45 -= l.x * x16; x45 -= l.y * x17; x45 -= l.z * x18; x45 -= l.w * x19; } { const v4f l = GDN_L4(45, 5); x45 -= l.x * x20; x45 -= l.y * x21; x45 -= l.z * x22; x45 -= l.w * x23; } { const v4f l = GDN_L4(45, 6); x45 -= l.x * x24; x45 -= l.y * x25; x45 -= l.z * x26; x45 -= l.w * x27; } { const v4f l = GDN_L4(45, 7); x45 -= l.x * x28; x45 -= l.y * x29; x45 -= l.z * x30; x45 -= l.w * x31; } { const v4f l = GDN_L4(45, 8); x45 -= l.x * x32; x45 -= l.y * x33; x45 -= l.z * x34; x45 -= l.w * x35; } { const v4f l = GDN_L4(45, 9); x45 -= l.x * x36; x45 -= l.y * x37; x45 -= l.z * x38; x45 -= l.w * x39; } { const v4f l = GDN_L4(45, 10); x45 -= l.x * x40; x45 -= l.y * x41; x45 -= l.z * x42; x45 -= l.w * x43; } { const v4f l = GDN_L4(45, 11); x45 -= l.x * x44; } __builtin_amdgcn_sched_barrier(0);
        float x46 = GDN_RHS(46); { const v4f l = GDN_L4(46, 0); x46 -= l.x * x0; x46 -= l.y * x1; x46 -= l.z * x2; x46 -= l.w * x3; } { const v4f l = GDN_L4(46, 1); x46 -= l.x * x4; x46 -= l.y * x5; x46 -= l.z * x6; x46 -= l.w * x7; } { const v4f l = GDN_L4(46, 2); x46 -= l.x * x8; x46 -= l.y * x9; x46 -= l.z * x10; x46 -= l.w * x11; } { const v4f l = GDN_L4(46, 3); x46 -= l.x * x12; x46 -= l.y * x13; x46 -= l.z * x14; x46 -= l.w * x15; } { const v4f l = GDN_L4(46, 4); x46 -= l.x * x16; x46 -= l.y * x17; x46 -= l.z * x18; x46 -= l.w * x19; } { const v4f l = GDN_L4(46, 5); x46 -= l.x * x20; x46 -= l.y * x21; x46 -= l.z * x22; x46 -= l.w * x23; } { const v4f l = GDN_L4(46, 6); x46 -= l.x * x24; x46 -= l.y * x25; x46 -= l.z * x26; x46 -= l.w * x27; } { const v4f l = GDN_L4(46, 7); x46 -= l.x * x28; x46 -= l.y * x29; x46 -= l.z * x30; x46 -= l.w * x31; } { const v4f l = GDN_L4(46, 8); x46 -= l.x * x32; x46 -= l.y * x33; x46 -= l.z * x34; x46 -= l.w * x35; } { const v4f l = GDN_L4(46, 9); x46 -= l.x * x36; x46 -= l.y * x37; x46 -= l.z * x38; x46 -= l.w * x39; } { const v4f l = GDN_L4(46, 10); x46 -= l.x * x40; x46 -= l.y * x41; x46 -= l.z * x42; x46 -= l.w * x43; } { const v4f l = GDN_L4(46, 11); x46 -= l.x * x44; x46 -= l.y * x45; } __builtin_amdgcn_sched_barrier(0);
        float x47 = GDN_RHS(47); { const v4f l = GDN_L4(47, 0); x47 -= l.x * x0; x47 -= l.y * x1; x47 -= l.z * x2; x47 -= l.w * x3; } { const v4f l = GDN_L4(47, 1); x47 -= l.x * x4; x47 -= l.y * x5; x47 -= l.z * x6; x47 -= l.w * x7; } { const v4f l = GDN_L4(47, 2); x47 -= l.x * x8; x47 -= l.y * x9; x47 -= l.z * x10; x47 -= l.w * x11; } { const v4f l = GDN_L4(47, 3); x47 -= l.x * x12; x47 -= l.y * x13; x47 -= l.z * x14; x47 -= l.w * x15; } { const v4f l = GDN_L4(47, 4); x47 -= l.x * x16; x47 -= l.y * x17; x47 -= l.z * x18; x47 -= l.w * x19; } { const v4f l = GDN_L4(47, 5); x47 -= l.x * x20; x47 -= l.y * x21; x47 -= l.z * x22; x47 -= l.w * x23; } { const v4f l = GDN_L4(47, 6); x47 -= l.x * x24; x47 -= l.y * x25; x47 -= l.z * x26; x47 -= l.w * x27; } { const v4f l = GDN_L4(47, 7); x47 -= l.x * x28; x47 -= l.y * x29; x47 -= l.z * x30; x47 -= l.w * x31; } { const v4f l = GDN_L4(47, 8); x47 -= l.x * x32; x47 -= l.y * x33; x47 -= l.z * x34; x47 -= l.w * x35; } { const v4f l = GDN_L4(47, 9); x47 -= l.x * x36; x47 -= l.y * x37; x47 -= l.z * x38; x47 -= l.w * x39; } { const v4f l = GDN_L4(47, 10); x47 -= l.x * x40; x47 -= l.y * x41; x47 -= l.z * x42; x47 -= l.w * x43; } { const v4f l = GDN_L4(47, 11); x47 -= l.x * x44; x47 -= l.y * x45; x47 -= l.z * x46; } __builtin_amdgcn_sched_barrier(0);
        float x48 = GDN_RHS(48); { const v4f l = GDN_L4(48, 0); x48 -= l.x * x0; x48 -= l.y * x1; x48 -= l.z * x2; x48 -= l.w * x3; } { const v4f l = GDN_L4(48, 1); x48 -= l.x * x4; x48 -= l.y * x5; x48 -= l.z * x6; x48 -= l.w * x7; } { const v4f l = GDN_L4(48, 2); x48 -= l.x * x8; x48 -= l.y * x9; x48 -= l.z * x10; x48 -= l.w * x11; } { const v4f l = GDN_L4(48, 3); x48 -= l.x * x12; x48 -= l.y * x13; x48 -= l.z * x14; x48 -= l.w * x15; } { const v4f l = GDN_L4(48, 4); x48 -= l.x * x16; x48 -= l.y * x17; x48 -= l.z * x18; x48 -= l.w * x19; } { const v4f l = GDN_L4(48, 5); x48 -= l.x * x20; x48 -= l.y * x21; x48 -= l.z * x22; x48 -= l.w * x23; } { const v4f l = GDN_L4(48, 6); x48 -= l.x * x24; x48 -= l.y * x25; x48 -= l.z * x26; x48 -= l.w * x27; } { const v4f l = GDN_L4(48, 7); x48 -= l.x * x28; x48 -= l.y * x29; x48 -= l.z * x30; x48 -= l.w * x31; } { const v4f l = GDN_L4(48, 8); x48 -= l.x * x32; x48 -= l.y * x33; x48 -= l.z * x34; x48 -= l.w * x35; } { const v4f l = GDN_L4(48, 9); x48 -= l.x * x36; x48 -= l.y * x37; x48 -= l.z * x38; x48 -= l.w * x39; } { const v4f l = GDN_L4(48, 10); x48 -= l.x * x40; x48 -= l.y * x41; x48 -= l.z * x42; x48 -= l.w * x43; } { const v4f l = GDN_L4(48, 11); x48 -= l.x * x44; x48 -= l.y * x45; x48 -= l.z * x46; x48 -= l.w * x47; } __builtin_amdgcn_sched_barrier(0);
        float x49 = GDN_RHS(49); { const v4f l = GDN_L4(49, 0); x49 -= l.x * x0; x49 -= l.y * x1; x49 -= l.z * x2; x49 -= l.w * x3; } { const v4f l = GDN_L4(49, 1); x49 -= l.x * x4; x49 -= l.y * x5; x49 -= l.z * x6; x49 -= l.w * x7; } { const v4f l = GDN_L4(49, 2); x49 -= l.x * x8; x49 -= l.y * x9; x49 -= l.z * x10; x49 -= l.w * x11; } { const v4f l = GDN_L4(49, 3); x49 -= l.x * x12; x49 -= l.y * x13; x49 -= l.z * x14; x49 -= l.w * x15; } { const v4f l = GDN_L4(49, 4); x49 -= l.x * x16; x49 -= l.y * x17; x49 -= l.z * x18; x49 -= l.w * x19; } { const v4f l = GDN_L4(49, 5); x49 -= l.x * x20; x49 -= l.y * x21; x49 -= l.z * x22; x49 -= l.w * x23; } { const v4f l = GDN_L4(49, 6); x49 -= l.x * x24; x49 -= l.y * x25; x49 -= l.z * x26; x49 -= l.w * x27; } { const v4f l = GDN_L4(49, 7); x49 -= l.x * x28; x49 -= l.y * x29; x49 -= l.z * x30; x49 -= l.w * x31; } { const v4f l = GDN_L4(49, 8); x49 -= l.x * x32; x49 -= l.y * x33; x49 -= l.z * x34; x49 -= l.w * x35; } { const v4f l = GDN_L4(49, 9); x49 -= l.x * x36; x49 -= l.y * x37; x49 -= l.z * x38; x49 -= l.w * x39; } { const v4f l = GDN_L4(49, 10); x49 -= l.x * x40; x49 -= l.y * x41; x49 -= l.z * x42; x49 -= l.w * x43; } { const v4f l = GDN_L4(49, 11); x49 -= l.x * x44; x49 -= l.y * x45; x49 -= l.z * x46; x49 -= l.w * x47; } { const v4f l = GDN_L4(49, 12); x49 -= l.x * x48; } __builtin_amdgcn_sched_barrier(0);
        float x50 = GDN_RHS(50); { const v4f l = GDN_L4(50, 0); x50 -= l.x * x0; x50 -= l.y * x1; x50 -= l.z * x2; x50 -= l.w * x3; } { const v4f l = GDN_L4(50, 1); x50 -= l.x * x4; x50 -= l.y * x5; x50 -= l.z * x6; x50 -= l.w * x7; } { const v4f l = GDN_L4(50, 2); x50 -= l.x * x8; x50 -= l.y * x9; x50 -= l.z * x10; x50 -= l.w * x11; } { const v4f l = GDN_L4(50, 3); x50 -= l.x * x12; x50 -= l.y * x13; x50 -= l.z * x14; x50 -= l.w * x15; } { const v4f l = GDN_L4(50, 4); x50 -= l.x * x16; x50 -= l.y * x17; x50 -= l.z * x18; x50 -= l.w * x19; } { const v4f l = GDN_L4(50, 5); x50 -= l.x * x20; x50 -= l.y * x21; x50 -= l.z * x22; x50 -= l.w * x23; } { const v4f l = GDN_L4(50, 6); x50 -= l.x * x24; x50 -= l.y * x25; x50 -= l.z * x26; x50 -= l.w * x27; } { const v4f l = GDN_L4(50, 7); x50 -= l.x * x28; x50 -= l.y * x29; x50 -= l.z * x30; x50 -= l.w * x31; } { const v4f l = GDN_L4(50, 8); x50 -= l.x * x32; x50 -= l.y * x33; x50 -= l.z * x34; x50 -= l.w * x35; } { const v4f l = GDN_L4(50, 9); x50 -= l.x * x36; x50 -= l.y * x37; x50 -= l.z * x38; x50 -= l.w * x39; } { const v4f l = GDN_L4(50, 10); x50 -= l.x * x40; x50 -= l.y * x41; x50 -= l.z * x42; x50 -= l.w * x43; } { const v4f l = GDN_L4(50, 11); x50 -= l.x * x44; x50 -= l.y * x45; x50 -= l.z * x46; x50 -= l.w * x47; } { const v4f l = GDN_L4(50, 12); x50 -= l.x * x48; x50 -= l.y * x49; } __builtin_amdgcn_sched_barrier(0);
        float x51 = GDN_RHS(51); { const v4f l = GDN_L4(51, 0); x51 -= l.x * x0; x51 -= l.y * x1; x51 -= l.z * x2; x51 -= l.w * x3; } { const v4f l = GDN_L4(51, 1); x51 -= l.x * x4; x51 -= l.y * x5; x51 -= l.z * x6; x51 -= l.w * x7; } { const v4f l = GDN_L4(51, 2); x51 -= l.x * x8; x51 -= l.y * x9; x51 -= l.z * x10; x51 -= l.w * x11; } { const v4f l = GDN_L4(51, 3); x51 -= l.x * x12; x51 -= l.y * x13; x51 -= l.z * x14; x51 -= l.w * x15; } { const v4f l = GDN_L4(51, 4); x51 -= l.x * x16; x51 -= l.y * x17; x51 -= l.z * x18; x51 -= l.w * x19; } { const v4f l = GDN_L4(51, 5); x51 -= l.x * x20; x51 -= l.y * x21; x51 -= l.z * x22; x51 -= l.w * x23; } { const v4f l = GDN_L4(51, 6); x51 -= l.x * x24; x51 -= l.y * x25; x51 -= l.z * x26; x51 -= l.w * x27; } { const v4f l = GDN_L4(51, 7); x51 -= l.x * x28; x51 -= l.y * x29; x51 -= l.z * x30; x51 -= l.w * x31; } { const v4f l = GDN_L4(51, 8); x51 -= l.x * x32; x51 -= l.y * x33; x51 -= l.z * x34; x51 -= l.w * x35; } { const v4f l = GDN_L4(51, 9); x51 -= l.x * x36; x51 -= l.y * x37; x51 -= l.z * x38; x51 -= l.w * x39; } { const v4f l = GDN_L4(51, 10); x51 -= l.x * x40; x51 -= l.y * x41; x51 -= l.z * x42; x51 -= l.w * x43; } { const v4f l = GDN_L4(51, 11); x51 -= l.x * x44; x51 -= l.y * x45; x51 -= l.z * x46; x51 -= l.w * x47; } { const v4f l = GDN_L4(51, 12); x51 -= l.x * x48; x51 -= l.y * x49; x51 -= l.z * x50; } __builtin_amdgcn_sched_barrier(0);
        float x52 = GDN_RHS(52); { const v4f l = GDN_L4(52, 0); x52 -= l.x * x0; x52 -= l.y * x1; x52 -= l.z * x2; x52 -= l.w * x3; } { const v4f l = GDN_L4(52, 1); x52 -= l.x * x4; x52 -= l.y * x5; x52 -= l.z * x6; x52 -= l.w * x7; } { const v4f l = GDN_L4(52, 2); x52 -= l.x * x8; x52 -= l.y * x9; x52 -= l.z * x10; x52 -= l.w * x11; } { const v4f l = GDN_L4(52, 3); x52 -= l.x * x12; x52 -= l.y * x13; x52 -= l.z * x14; x52 -= l.w * x15; } { const v4f l = GDN_L4(52, 4); x52 -= l.x * x16; x52 -= l.y * x17; x52 -= l.z * x18; x52 -= l.w * x19; } { const v4f l = GDN_L4(52, 5); x52 -= l.x * x20; x52 -= l.y * x21; x52 -= l.z * x22; x52 -= l.w * x23; } { const v4f l = GDN_L4(52, 6); x52 -= l.x * x24; x52 -= l.y * x25; x52 -= l.z * x26; x52 -= l.w * x27; } { const v4f l = GDN_L4(52, 7); x52 -= l.x * x28; x52 -= l.y * x29; x52 -= l.z * x30; x52 -= l.w * x31; } { const v4f l = GDN_L4(52, 8); x52 -= l.x * x32; x52 -= l.y * x33; x52 -= l.z * x34; x52 -= l.w * x35; } { const v4f l = GDN_L4(52, 9); x52 -= l.x * x36; x52 -= l.y * x37; x52 -= l.z * x38; x52 -= l.w * x39; } { const v4f l = GDN_L4(52, 10); x52 -= l.x * x40; x52 -= l.y * x41; x52 -= l.z * x42; x52 -= l.w * x43; } { const v4f l = GDN_L4(52, 11); x52 -= l.x * x44; x52 -= l.y * x45; x52 -= l.z * x46; x52 -= l.w * x47; } { const v4f l = GDN_L4(52, 12); x52 -= l.x * x48; x52 -= l.y * x49; x52 -= l.z * x50; x52 -= l.w * x51; } __builtin_amdgcn_sched_barrier(0);
        float x53 = GDN_RHS(53); { const v4f l = GDN_L4(53, 0); x53 -= l.x * x0; x53 -= l.y * x1; x53 -= l.z * x2; x53 -= l.w * x3; } { const v4f l = GDN_L4(53, 1); x53 -= l.x * x4; x53 -= l.y * x5; x53 -= l.z * x6; x53 -= l.w * x7; } { const v4f l = GDN_L4(53, 2); x53 -= l.x * x8; x53 -= l.y * x9; x53 -= l.z * x10; x53 -= l.w * x11; } { const v4f l = GDN_L4(53, 3); x53 -= l.x * x12; x53 -= l.y * x13; x53 -= l.z * x14; x53 -= l.w * x15; } { const v4f l = GDN_L4(53, 4); x53 -= l.x * x16; x53 -= l.y * x17; x53 -= l.z * x18; x53 -= l.w * x19; } { const v4f l = GDN_L4(53, 5); x53 -= l.x * x20; x53 -= l.y * x21; x53 -= l.z * x22; x53 -= l.w * x23; } { const v4f l = GDN_L4(53, 6); x53 -= l.x * x24; x53 -= l.y * x25; x53 -= l.z * x26; x53 -= l.w * x27; } { const v4f l = GDN_L4(53, 7); x53 -= l.x * x28; x53 -= l.y * x29; x53 -= l.z * x30; x53 -= l.w * x31; } { const v4f l = GDN_L4(53, 8); x53 -= l.x * x32; x53 -= l.y * x33; x53 -= l.z * x34; x53 -= l.w * x35; } { const v4f l = GDN_L4(53, 9); x53 -= l.x * x36; x53 -= l.y * x37; x53 -= l.z * x38; x53 -= l.w * x39; } { const v4f l = GDN_L4(53, 10); x53 -= l.x * x40; x53 -= l.y * x41; x53 -= l.z * x42; x53 -= l.w * x43; } { const v4f l = GDN_L4(53, 11); x53 -= l.x * x44; x53 -= l.y * x45; x53 -= l.z * x46; x53 -= l.w * x47; } { const v4f l = GDN_L4(53, 12); x53 -= l.x * x48; x53 -= l.y * x49; x53 -= l.z * x50; x53 -= l.w * x51; } { const v4f l = GDN_L4(53, 13); x53 -= l.x * x52; } __builtin_amdgcn_sched_barrier(0);
        float x54 = GDN_RHS(54); { const v4f l = GDN_L4(54, 0); x54 -= l.x * x0; x54 -= l.y * x1; x54 -= l.z * x2; x54 -= l.w * x3; } { const v4f l = GDN_L4(54, 1); x54 -= l.x * x4; x54 -= l.y * x5; x54 -= l.z * x6; x54 -= l.w * x7; } { const v4f l = GDN_L4(54, 2); x54 -= l.x * x8; x54 -= l.y * x9; x54 -= l.z * x10; x54 -= l.w * x11; } { const v4f l = GDN_L4(54, 3); x54 -= l.x * x12; x54 -= l.y * x13; x54 -= l.z * x14; x54 -= l.w * x15; } { const v4f l = GDN_L4(54, 4); x54 -= l.x * x16; x54 -= l.y * x17; x54 -= l.z * x18; x54 -= l.w * x19; } { const v4f l = GDN_L4(54, 5); x54 -= l.x * x20; x54 -= l.y * x21; x54 -= l.z * x22; x54 -= l.w * x23; } { const v4f l = GDN_L4(54, 6); x54 -= l.x * x24; x54 -= l.y * x25; x54 -= l.z * x26; x54 -= l.w * x27; } { const v4f l = GDN_L4(54, 7); x54 -= l.x * x28; x54 -= l.y * x29; x54 -= l.z * x30; x54 -= l.w * x31; } { const v4f l = GDN_L4(54, 8); x54 -= l.x * x32; x54 -= l.y * x33; x54 -= l.z * x34; x54 -= l.w * x35; } { const v4f l = GDN_L4(54, 9); x54 -= l.x * x36; x54 -= l.y * x37; x54 -= l.z * x38; x54 -= l.w * x39; } { const v4f l = GDN_L4(54, 10); x54 -= l.x * x40; x54 -= l.y * x41; x54 -= l.z * x42; x54 -= l.w * x43; } { const v4f l = GDN_L4(54, 11); x54 -= l.x * x44; x54 -= l.y * x45; x54 -= l.z * x46; x54 -= l.w * x47; } { const v4f l = GDN_L4(54, 12); x54 -= l.x * x48; x54 -= l.y * x49; x54 -= l.z * x50; x54 -= l.w * x51; } { const v4f l = GDN_L4(54, 13); x54 -= l.x * x52; x54 -= l.y * x53; } __builtin_amdgcn_sched_barrier(0);
        float x55 = GDN_RHS(55); { const v4f l = GDN_L4(55, 0); x55 -= l.x * x0; x55 -= l.y * x1; x55 -= l.z * x2; x55 -= l.w * x3; } { const v4f l = GDN_L4(55, 1); x55 -= l.x * x4; x55 -= l.y * x5; x55 -= l.z * x6; x55 -= l.w * x7; } { const v4f l = GDN_L4(55, 2); x55 -= l.x * x8; x55 -= l.y * x9; x55 -= l.z * x10; x55 -= l.w * x11; } { const v4f l = GDN_L4(55, 3); x55 -= l.x * x12; x55 -= l.y * x13; x55 -= l.z * x14; x55 -= l.w * x15; } { const v4f l = GDN_L4(55, 4); x55 -= l.x * x16; x55 -= l.y * x17; x55 -= l.z * x18; x55 -= l.w * x19; } { const v4f l = GDN_L4(55, 5); x55 -= l.x * x20; x55 -= l.y * x21; x55 -= l.z * x22; x55 -= l.w * x23; } { const v4f l = GDN_L4(55, 6); x55 -= l.x * x24; x55 -= l.y * x25; x55 -= l.z * x26; x55 -= l.w * x27; } { const v4f l = GDN_L4(55, 7); x55 -= l.x * x28; x55 -= l.y * x29; x55 -= l.z * x30; x55 -= l.w * x31; } { const v4f l = GDN_L4(55, 8); x55 -= l.x * x32; x55 -= l.y * x33; x55 -= l.z * x34; x55 -= l.w * x35; } { const v4f l = GDN_L4(55, 9); x55 -= l.x * x36; x55 -= l.y * x37; x55 -= l.z * x38; x55 -= l.w * x39; } { const v4f l = GDN_L4(55, 10); x55 -= l.x * x40; x55 -= l.y * x41; x55 -= l.z * x42; x55 -= l.w * x43; } { const v4f l = GDN_L4(55, 11); x55 -= l.x * x44; x55 -= l.y * x45; x55 -= l.z * x46; x55 -= l.w * x47; } { const v4f l = GDN_L4(55, 12); x55 -= l.x * x48; x55 -= l.y * x49; x55 -= l.z * x50; x55 -= l.w * x51; } { const v4f l = GDN_L4(55, 13); x55 -= l.x * x52; x55 -= l.y * x53; x55 -= l.z * x54; } __builtin_amdgcn_sched_barrier(0);
        float x56 = GDN_RHS(56); { const v4f l = GDN_L4(56, 0); x56 -= l.x * x0; x56 -= l.y * x1; x56 -= l.z * x2; x56 -= l.w * x3; } { const v4f l = GDN_L4(56, 1); x56 -= l.x * x4; x56 -= l.y * x5; x56 -= l.z * x6; x56 -= l.w * x7; } { const v4f l = GDN_L4(56, 2); x56 -= l.x * x8; x56 -= l.y * x9; x56 -= l.z * x10; x56 -= l.w * x11; } { const v4f l = GDN_L4(56, 3); x56 -= l.x * x12; x56 -= l.y * x13; x56 -= l.z * x14; x56 -= l.w * x15; } { const v4f l = GDN_L4(56, 4); x56 -= l.x * x16; x56 -= l.y * x17; x56 -= l.z * x18; x56 -= l.w * x19; } { const v4f l = GDN_L4(56, 5); x56 -= l.x * x20; x56 -= l.y * x21; x56 -= l.z * x22; x56 -= l.w * x23; } { const v4f l = GDN_L4(56, 6); x56 -= l.x * x24; x56 -= l.y * x25; x56 -= l.z * x26; x56 -= l.w * x27; } { const v4f l = GDN_L4(56, 7); x56 -= l.x * x28; x56 -= l.y * x29; x56 -= l.z * x30; x56 -= l.w * x31; } { const v4f l = GDN_L4(56, 8); x56 -= l.x * x32; x56 -= l.y * x33; x56 -= l.z * x34; x56 -= l.w * x35; } { const v4f l = GDN_L4(56, 9); x56 -= l.x * x36; x56 -= l.y * x37; x56 -= l.z * x38; x56 -= l.w * x39; } { const v4f l = GDN_L4(56, 10); x56 -= l.x * x40; x56 -= l.y * x41; x56 -= l.z * x42; x56 -= l.w * x43; } { const v4f l = GDN_L4(56, 11); x56 -= l.x * x44; x56 -= l.y * x45; x56 -= l.z * x46; x56 -= l.w * x47; } { const v4f l = GDN_L4(56, 12); x56 -= l.x * x48; x56 -= l.y * x49; x56 -= l.z * x50; x56 -= l.w * x51; } { const v4f l = GDN_L4(56, 13); x56 -= l.x * x52; x56 -= l.y * x53; x56 -= l.z * x54; x56 -= l.w * x55; } __builtin_amdgcn_sched_barrier(0);
        float x57 = GDN_RHS(57); { const v4f l = GDN_L4(57, 0); x57 -= l.x * x0; x57 -= l.y * x1; x57 -= l.z * x2; x57 -= l.w * x3; } { const v4f l = GDN_L4(57, 1); x57 -= l.x * x4; x57 -= l.y * x5; x57 -= l.z * x6; x57 -= l.w * x7; } { const v4f l = GDN_L4(57, 2); x57 -= l.x * x8; x57 -= l.y * x9; x57 -= l.z * x10; x57 -= l.w * x11; } { const v4f l = GDN_L4(57, 3); x57 -= l.x * x12; x57 -= l.y * x13; x57 -= l.z * x14; x57 -= l.w * x15; } { const v4f l = GDN_L4(57, 4); x57 -= l.x * x16; x57 -= l.y * x17; x57 -= l.z * x18; x57 -= l.w * x19; } { const v4f l = GDN_L4(57, 5); x57 -= l.x * x20; x57 -= l.y * x21; x57 -= l.z * x22; x57 -= l.w * x23; } { const v4f l = GDN_L4(57, 6); x57 -= l.x * x24; x57 -= l.y * x25; x57 -= l.z * x26; x57 -= l.w * x27; } { const v4f l = GDN_L4(57, 7); x57 -= l.x * x28; x57 -= l.y * x29; x57 -= l.z * x30; x57 -= l.w * x31; } { const v4f l = GDN_L4(57, 8); x57 -= l.x * x32; x57 -= l.y * x33; x57 -= l.z * x34; x57 -= l.w * x35; } { const v4f l = GDN_L4(57, 9); x57 -= l.x * x36; x57 -= l.y * x37; x57 -= l.z * x38; x57 -= l.w * x39; } { const v4f l = GDN_L4(57, 10); x57 -= l.x * x40; x57 -= l.y * x41; x57 -= l.z * x42; x57 -= l.w * x43; } { const v4f l = GDN_L4(57, 11); x57 -= l.x * x44; x57 -= l.y * x45; x57 -= l.z * x46; x57 -= l.w * x47; } { const v4f l = GDN_L4(57, 12); x57 -= l.x * x48; x57 -= l.y * x49; x57 -= l.z * x50; x57 -= l.w * x51; } { const v4f l = GDN_L4(57, 13); x57 -= l.x * x52; x57 -= l.y * x53; x57 -= l.z * x54; x57 -= l.w * x55; } { const v4f l = GDN_L4(57, 14); x57 -= l.x * x56; } __builtin_amdgcn_sched_barrier(0);
        float x58 = GDN_RHS(58); { const v4f l = GDN_L4(58, 0); x58 -= l.x * x0; x58 -= l.y * x1; x58 -= l.z * x2; x58 -= l.w * x3; } { const v4f l = GDN_L4(58, 1); x58 -= l.x * x4; x58 -= l.y * x5; x58 -= l.z * x6; x58 -= l.w * x7; } { const v4f l = GDN_L4(58, 2); x58 -= l.x * x8; x58 -= l.y * x9; x58 -= l.z * x10; x58 -= l.w * x11; } { const v4f l = GDN_L4(58, 3); x58 -= l.x * x12; x58 -= l.y * x13; x58 -= l.z * x14; x58 -= l.w * x15; } { const v4f l = GDN_L4(58, 4); x58 -= l.x * x16; x58 -= l.y * x17; x58 -= l.z * x18; x58 -= l.w * x19; } { const v4f l = GDN_L4(58, 5); x58 -= l.x * x20; x58 -= l.y * x21; x58 -= l.z * x22; x58 -= l.w * x23; } { const v4f l = GDN_L4(58, 6); x58 -= l.x * x24; x58 -= l.y * x25; x58 -= l.z * x26; x58 -= l.w * x27; } { const v4f l = GDN_L4(58, 7); x58 -= l.x * x28; x58 -= l.y * x29; x58 -= l.z * x30; x58 -= l.w * x31; } { const v4f l = GDN_L4(58, 8); x58 -= l.x * x32; x58 -= l.y * x33; x58 -= l.z * x34; x58 -= l.w * x35; } { const v4f l = GDN_L4(58, 9); x58 -= l.x * x36; x58 -= l.y * x37; x58 -= l.z * x38; x58 -= l.w * x39; } { const v4f l = GDN_L4(58, 10); x58 -= l.x * x40; x58 -= l.y * x41; x58 -= l.z * x42; x58 -= l.w * x43; } { const v4f l = GDN_L4(58, 11); x58 -= l.x * x44; x58 -= l.y * x45; x58 -= l.z * x46; x58 -= l.w * x47; } { const v4f l = GDN_L4(58, 12); x58 -= l.x * x48; x58 -= l.y * x49; x58 -= l.z * x50; x58 -= l.w * x51; } { const v4f l = GDN_L4(58, 13); x58 -= l.x * x52; x58 -= l.y * x53; x58 -= l.z * x54; x58 -= l.w * x55; } { const v4f l = GDN_L4(58, 14); x58 -= l.x * x56; x58 -= l.y * x57; } __builtin_amdgcn_sched_barrier(0);
        float x59 = GDN_RHS(59); { const v4f l = GDN_L4(59, 0); x59 -= l.x * x0; x59 -= l.y * x1; x59 -= l.z * x2; x59 -= l.w * x3; } { const v4f l = GDN_L4(59, 1); x59 -= l.x * x4; x59 -= l.y * x5; x59 -= l.z * x6; x59 -= l.w * x7; } { const v4f l = GDN_L4(59, 2); x59 -= l.x * x8; x59 -= l.y * x9; x59 -= l.z * x10; x59 -= l.w * x11; } { const v4f l = GDN_L4(59, 3); x59 -= l.x * x12; x59 -= l.y * x13; x59 -= l.z * x14; x59 -= l.w * x15; } { const v4f l = GDN_L4(59, 4); x59 -= l.x * x16; x59 -= l.y * x17; x59 -= l.z * x18; x59 -= l.w * x19; } { const v4f l = GDN_L4(59, 5); x59 -= l.x * x20; x59 -= l.y * x21; x59 -= l.z * x22; x59 -= l.w * x23; } { const v4f l = GDN_L4(59, 6); x59 -= l.x * x24; x59 -= l.y * x25; x59 -= l.z * x26; x59 -= l.w * x27; } { const v4f l = GDN_L4(59, 7); x59 -= l.x * x28; x59 -= l.y * x29; x59 -= l.z * x30; x59 -= l.w * x31; } { const v4f l = GDN_L4(59, 8); x59 -= l.x * x32; x59 -= l.y * x33; x59 -= l.z * x34; x59 -= l.w * x35; } { const v4f l = GDN_L4(59, 9); x59 -= l.x * x36; x59 -= l.y * x37; x59 -= l.z * x38; x59 -= l.w * x39; } { const v4f l = GDN_L4(59, 10); x59 -= l.x * x40; x59 -= l.y * x41; x59 -= l.z * x42; x59 -= l.w * x43; } { const v4f l = GDN_L4(59, 11); x59 -= l.x * x44; x59 -= l.y * x45; x59 -= l.z * x46; x59 -= l.w * x47; } { const v4f l = GDN_L4(59, 12); x59 -= l.x * x48; x59 -= l.y * x49; x59 -= l.z * x50; x59 -= l.w * x51; } { const v4f l = GDN_L4(59, 13); x59 -= l.x * x52; x59 -= l.y * x53; x59 -= l.z * x54; x59 -= l.w * x55; } { const v4f l = GDN_L4(59, 14); x59 -= l.x * x56; x59 -= l.y * x57; x59 -= l.z * x58; } __builtin_amdgcn_sched_barrier(0);
        float x60 = GDN_RHS(60); { const v4f l = GDN_L4(60, 0); x60 -= l.x * x0; x60 -= l.y * x1; x60 -= l.z * x2; x60 -= l.w * x3; } { const v4f l = GDN_L4(60, 1); x60 -= l.x * x4; x60 -= l.y * x5; x60 -= l.z * x6; x60 -= l.w * x7; } { const v4f l = GDN_L4(60, 2); x60 -= l.x * x8; x60 -= l.y * x9; x60 -= l.z * x10; x60 -= l.w * x11; } { const v4f l = GDN_L4(60, 3); x60 -= l.x * x12; x60 -= l.y * x13; x60 -= l.z * x14; x60 -= l.w * x15; } { const v4f l = GDN_L4(60, 4); x60 -= l.x * x16; x60 -= l.y * x17; x60 -= l.z * x18; x60 -= l.w * x19; } { const v4f l = GDN_L4(60, 5); x60 -= l.x * x20; x60 -= l.y * x21; x60 -= l.z * x22; x60 -= l.w * x23; } { const v4f l = GDN_L4(60, 6); x60 -= l.x * x24; x60 -= l.y * x25; x60 -= l.z * x26; x60 -= l.w * x27; } { const v4f l = GDN_L4(60, 7); x60 -= l.x * x28; x60 -= l.y * x29; x60 -= l.z * x30; x60 -= l.w * x31; } { const v4f l = GDN_L4(60, 8); x60 -= l.x * x32; x60 -= l.y * x33; x60 -= l.z * x34; x60 -= l.w * x35; } { const v4f l = GDN_L4(60, 9); x60 -= l.x * x36; x60 -= l.y * x37; x60 -= l.z * x38; x60 -= l.w * x39; } { const v4f l = GDN_L4(60, 10); x60 -= l.x * x40; x60 -= l.y * x41; x60 -= l.z * x42; x60 -= l.w * x43; } { const v4f l = GDN_L4(60, 11); x60 -= l.x * x44; x60 -= l.y * x45; x60 -= l.z * x46; x60 -= l.w * x47; } { const v4f l = GDN_L4(60, 12); x60 -= l.x * x48; x60 -= l.y * x49; x60 -= l.z * x50; x60 -= l.w * x51; } { const v4f l = GDN_L4(60, 13); x60 -= l.x * x52; x60 -= l.y * x53; x60 -= l.z * x54; x60 -= l.w * x55; } { const v4f l = GDN_L4(60, 14); x60 -= l.x * x56; x60 -= l.y * x57; x60 -= l.z * x58; x60 -= l.w * x59; } __builtin_amdgcn_sched_barrier(0);
        float x61 = GDN_RHS(61); { const v4f l = GDN_L4(61, 0); x61 -= l.x * x0; x61 -= l.y * x1; x61 -= l.z * x2; x61 -= l.w * x3; } { const v4f l = GDN_L4(61, 1); x61 -= l.x * x4; x61 -= l.y * x5; x61 -= l.z * x6; x61 -= l.w * x7; } { const v4f l = GDN_L4(61, 2); x61 -= l.x * x8; x61 -= l.y * x9; x61 -= l.z * x10; x61 -= l.w * x11; } { const v4f l = GDN_L4(61, 3); x61 -= l.x * x12; x61 -= l.y * x13; x61 -= l.z * x14; x61 -= l.w * x15; } { const v4f l = GDN_L4(61, 4); x61 -= l.x * x16; x61 -= l.y * x17; x61 -= l.z * x18; x61 -= l.w * x19; } { const v4f l = GDN_L4(61, 5); x61 -= l.x * x20; x61 -= l.y * x21; x61 -= l.z * x22; x61 -= l.w * x23; } { const v4f l = GDN_L4(61, 6); x61 -= l.x * x24; x61 -= l.y * x25; x61 -= l.z * x26; x61 -= l.w * x27; } { const v4f l = GDN_L4(61, 7); x61 -= l.x * x28; x61 -= l.y * x29; x61 -= l.z * x30; x61 -= l.w * x31; } { const v4f l = GDN_L4(61, 8); x61 -= l.x * x32; x61 -= l.y * x33; x61 -= l.z * x34; x61 -= l.w * x35; } { const v4f l = GDN_L4(61, 9); x61 -= l.x * x36; x61 -= l.y * x37; x61 -= l.z * x38; x61 -= l.w * x39; } { const v4f l = GDN_L4(61, 10); x61 -= l.x * x40; x61 -= l.y * x41; x61 -= l.z * x42; x61 -= l.w * x43; } { const v4f l = GDN_L4(61, 11); x61 -= l.x * x44; x61 -= l.y * x45; x61 -= l.z * x46; x61 -= l.w * x47; } { const v4f l = GDN_L4(61, 12); x61 -= l.x * x48; x61 -= l.y * x49; x61 -= l.z * x50; x61 -= l.w * x51; } { const v4f l = GDN_L4(61, 13); x61 -= l.x * x52; x61 -= l.y * x53; x61 -= l.z * x54; x61 -= l.w * x55; } { const v4f l = GDN_L4(61, 14); x61 -= l.x * x56; x61 -= l.y * x57; x61 -= l.z * x58; x61 -= l.w * x59; } { const v4f l = GDN_L4(61, 15); x61 -= l.x * x60; } __builtin_amdgcn_sched_barrier(0);
        float x62 = GDN_RHS(62); { const v4f l = GDN_L4(62, 0); x62 -= l.x * x0; x62 -= l.y * x1; x62 -= l.z * x2; x62 -= l.w * x3; } { const v4f l = GDN_L4(62, 1); x62 -= l.x * x4; x62 -= l.y * x5; x62 -= l.z * x6; x62 -= l.w * x7; } { const v4f l = GDN_L4(62, 2); x62 -= l.x * x8; x62 -= l.y * x9; x62 -= l.z * x10; x62 -= l.w * x11; } { const v4f l = GDN_L4(62, 3); x62 -= l.x * x12; x62 -= l.y * x13; x62 -= l.z * x14; x62 -= l.w * x15; } { const v4f l = GDN_L4(62, 4); x62 -= l.x * x16; x62 -= l.y * x17; x62 -= l.z * x18; x62 -= l.w * x19; } { const v4f l = GDN_L4(62, 5); x62 -= l.x * x20; x62 -= l.y * x21; x62 -= l.z * x22; x62 -= l.w * x23; } { const v4f l = GDN_L4(62, 6); x62 -= l.x * x24; x62 -= l.y * x25; x62 -= l.z * x26; x62 -= l.w * x27; } { const v4f l = GDN_L4(62, 7); x62 -= l.x * x28; x62 -= l.y * x29; x62 -= l.z * x30; x62 -= l.w * x31; } { const v4f l = GDN_L4(62, 8); x62 -= l.x * x32; x62 -= l.y * x33; x62 -= l.z * x34; x62 -= l.w * x35; } { const v4f l = GDN_L4(62, 9); x62 -= l.x * x36; x62 -= l.y * x37; x62 -= l.z * x38; x62 -= l.w * x39; } { const v4f l = GDN_L4(62, 10); x62 -= l.x * x40; x62 -= l.y * x41; x62 -= l.z * x42; x62 -= l.w * x43; } { const v4f l = GDN_L4(62, 11); x62 -= l.x * x44; x62 -= l.y * x45; x62 -= l.z * x46; x62 -= l.w * x47; } { const v4f l = GDN_L4(62, 12); x62 -= l.x * x48; x62 -= l.y * x49; x62 -= l.z * x50; x62 -= l.w * x51; } { const v4f l = GDN_L4(62, 13); x62 -= l.x * x52; x62 -= l.y * x53; x62 -= l.z * x54; x62 -= l.w * x55; } { const v4f l = GDN_L4(62, 14); x62 -= l.x * x56; x62 -= l.y * x57; x62 -= l.z * x58; x62 -= l.w * x59; } { const v4f l = GDN_L4(62, 15); x62 -= l.x * x60; x62 -= l.y * x61; } __builtin_amdgcn_sched_barrier(0);
        float x63 = GDN_RHS(63); { const v4f l = GDN_L4(63, 0); x63 -= l.x * x0; x63 -= l.y * x1; x63 -= l.z * x2; x63 -= l.w * x3; } { const v4f l = GDN_L4(63, 1); x63 -= l.x * x4; x63 -= l.y * x5; x63 -= l.z * x6; x63 -= l.w * x7; } { const v4f l = GDN_L4(63, 2); x63 -= l.x * x8; x63 -= l.y * x9; x63 -= l.z * x10; x63 -= l.w * x11; } { const v4f l = GDN_L4(63, 3); x63 -= l.x * x12; x63 -= l.y * x13; x63 -= l.z * x14; x63 -= l.w * x15; } { const v4f l = GDN_L4(63, 4); x63 -= l.x * x16; x63 -= l.y * x17; x63 -= l.z * x18; x63 -= l.w * x19; } { const v4f l = GDN_L4(63, 5); x63 -= l.x * x20; x63 -= l.y * x21; x63 -= l.z * x22; x63 -= l.w * x23; } { const v4f l = GDN_L4(63, 6); x63 -= l.x * x24; x63 -= l.y * x25; x63 -= l.z * x26; x63 -= l.w * x27; } { const v4f l = GDN_L4(63, 7); x63 -= l.x * x28; x63 -= l.y * x29; x63 -= l.z * x30; x63 -= l.w * x31; } { const v4f l = GDN_L4(63, 8); x63 -= l.x * x32; x63 -= l.y * x33; x63 -= l.z * x34; x63 -= l.w * x35; } { const v4f l = GDN_L4(63, 9); x63 -= l.x * x36; x63 -= l.y * x37; x63 -= l.z * x38; x63 -= l.w * x39; } { const v4f l = GDN_L4(63, 10); x63 -= l.x * x40; x63 -= l.y * x41; x63 -= l.z * x42; x63 -= l.w * x43; } { const v4f l = GDN_L4(63, 11); x63 -= l.x * x44; x63 -= l.y * x45; x63 -= l.z * x46; x63 -= l.w * x47; } { const v4f l = GDN_L4(63, 12); x63 -= l.x * x48; x63 -= l.y * x49; x63 -= l.z * x50; x63 -= l.w * x51; } { const v4f l = GDN_L4(63, 13); x63 -= l.x * x52; x63 -= l.y * x53; x63 -= l.z * x54; x63 -= l.w * x55; } { const v4f l = GDN_L4(63, 14); x63 -= l.x * x56; x63 -= l.y * x57; x63 -= l.z * x58; x63 -= l.w * x59; } { const v4f l = GDN_L4(63, 15); x63 -= l.x * x60; x63 -= l.y * x61; x63 -= l.z * x62; } __builtin_amdgcn_sched_barrier(0);
        if (c < 128) { GU[0 * 128 + c] = x0; GU[1 * 128 + c] = x1; GU[2 * 128 + c] = x2; GU[3 * 128 + c] = x3; GU[4 * 128 + c] = x4; GU[5 * 128 + c] = x5; GU[6 * 128 + c] = x6; GU[7 * 128 + c] = x7; GU[8 * 128 + c] = x8; GU[9 * 128 + c] = x9; GU[10 * 128 + c] = x10; GU[11 * 128 + c] = x11; GU[12 * 128 + c] = x12; GU[13 * 128 + c] = x13; GU[14 * 128 + c] = x14; GU[15 * 128 + c] = x15; GU[16 * 128 + c] = x16; GU[17 * 128 + c] = x17; GU[18 * 128 + c] = x18; GU[19 * 128 + c] = x19; GU[20 * 128 + c] = x20; GU[21 * 128 + c] = x21; GU[22 * 128 + c] = x22; GU[23 * 128 + c] = x23; GU[24 * 128 + c] = x24; GU[25 * 128 + c] = x25; GU[26 * 128 + c] = x26; GU[27 * 128 + c] = x27; GU[28 * 128 + c] = x28; GU[29 * 128 + c] = x29; GU[30 * 128 + c] = x30; GU[31 * 128 + c] = x31; GU[32 * 128 + c] = x32; GU[33 * 128 + c] = x33; GU[34 * 128 + c] = x34; GU[35 * 128 + c] = x35; GU[36 * 128 + c] = x36; GU[37 * 128 + c] = x37; GU[38 * 128 + c] = x38; GU[39 * 128 + c] = x39; GU[40 * 128 + c] = x40; GU[41 * 128 + c] = x41; GU[42 * 128 + c] = x42; GU[43 * 128 + c] = x43; GU[44 * 128 + c] = x44; GU[45 * 128 + c] = x45; GU[46 * 128 + c] = x46; GU[47 * 128 + c] = x47; GU[48 * 128 + c] = x48; GU[49 * 128 + c] = x49; GU[50 * 128 + c] = x50; GU[51 * 128 + c] = x51; GU[52 * 128 + c] = x52; GU[53 * 128 + c] = x53; GU[54 * 128 + c] = x54; GU[55 * 128 + c] = x55; GU[56 * 128 + c] = x56; GU[57 * 128 + c] = x57; GU[58 * 128 + c] = x58; GU[59 * 128 + c] = x59; GU[60 * 128 + c] = x60; GU[61 * 128 + c] = x61; GU[62 * 128 + c] = x62; GU[63 * 128 + c] = x63; }
        else { GNW[0 * 128 + (c - 128)] = (bf16)f2bf(-x0); GNW[1 * 128 + (c - 128)] = (bf16)f2bf(-x1); GNW[2 * 128 + (c - 128)] = (bf16)f2bf(-x2); GNW[3 * 128 + (c - 128)] = (bf16)f2bf(-x3); GNW[4 * 128 + (c - 128)] = (bf16)f2bf(-x4); GNW[5 * 128 + (c - 128)] = (bf16)f2bf(-x5); GNW[6 * 128 + (c - 128)] = (bf16)f2bf(-x6); GNW[7 * 128 + (c - 128)] = (bf16)f2bf(-x7); GNW[8 * 128 + (c - 128)] = (bf16)f2bf(-x8); GNW[9 * 128 + (c - 128)] = (bf16)f2bf(-x9); GNW[10 * 128 + (c - 128)] = (bf16)f2bf(-x10); GNW[11 * 128 + (c - 128)] = (bf16)f2bf(-x11); GNW[12 * 128 + (c - 128)] = (bf16)f2bf(-x12); GNW[13 * 128 + (c - 128)] = (bf16)f2bf(-x13); GNW[14 * 128 + (c - 128)] = (bf16)f2bf(-x14); GNW[15 * 128 + (c - 128)] = (bf16)f2bf(-x15); GNW[16 * 128 + (c - 128)] = (bf16)f2bf(-x16); GNW[17 * 128 + (c - 128)] = (bf16)f2bf(-x17); GNW[18 * 128 + (c - 128)] = (bf16)f2bf(-x18); GNW[19 * 128 + (c - 128)] = (bf16)f2bf(-x19); GNW[20 * 128 + (c - 128)] = (bf16)f2bf(-x20); GNW[21 * 128 + (c - 128)] = (bf16)f2bf(-x21); GNW[22 * 128 + (c - 128)] = (bf16)f2bf(-x22); GNW[23 * 128 + (c - 128)] = (bf16)f2bf(-x23); GNW[24 * 128 + (c - 128)] = (bf16)f2bf(-x24); GNW[25 * 128 + (c - 128)] = (bf16)f2bf(-x25); GNW[26 * 128 + (c - 128)] = (bf16)f2bf(-x26); GNW[27 * 128 + (c - 128)] = (bf16)f2bf(-x27); GNW[28 * 128 + (c - 128)] = (bf16)f2bf(-x28); GNW[29 * 128 + (c - 128)] = (bf16)f2bf(-x29); GNW[30 * 128 + (c - 128)] = (bf16)f2bf(-x30); GNW[31 * 128 + (c - 128)] = (bf16)f2bf(-x31); GNW[32 * 128 + (c - 128)] = (bf16)f2bf(-x32); GNW[33 * 128 + (c - 128)] = (bf16)f2bf(-x33); GNW[34 * 128 + (c - 128)] = (bf16)f2bf(-x34); GNW[35 * 128 + (c - 128)] = (bf16)f2bf(-x35); GNW[36 * 128 + (c - 128)] = (bf16)f2bf(-x36); GNW[37 * 128 + (c - 128)] = (bf16)f2bf(-x37); GNW[38 * 128 + (c - 128)] = (bf16)f2bf(-x38); GNW[39 * 128 + (c - 128)] = (bf16)f2bf(-x39); GNW[40 * 128 + (c - 128)] = (bf16)f2bf(-x40); GNW[41 * 128 + (c - 128)] = (bf16)f2bf(-x41); GNW[42 * 128 + (c - 128)] = (bf16)f2bf(-x42); GNW[43 * 128 + (c - 128)] = (bf16)f2bf(-x43); GNW[44 * 128 + (c - 128)] = (bf16)f2bf(-x44); GNW[45 * 128 + (c - 128)] = (bf16)f2bf(-x45); GNW[46 * 128 + (c - 128)] = (bf16)f2bf(-x46); GNW[47 * 128 + (c - 128)] = (bf16)f2bf(-x47); GNW[48 * 128 + (c - 128)] = (bf16)f2bf(-x48); GNW[49 * 128 + (c - 128)] = (bf16)f2bf(-x49); GNW[50 * 128 + (c - 128)] = (bf16)f2bf(-x50); GNW[51 * 128 + (c - 128)] = (bf16)f2bf(-x51); GNW[52 * 128 + (c - 128)] = (bf16)f2bf(-x52); GNW[53 * 128 + (c - 128)] = (bf16)f2bf(-x53); GNW[54 * 128 + (c - 128)] = (bf16)f2bf(-x54); GNW[55 * 128 + (c - 128)] = (bf16)f2bf(-x55); GNW[56 * 128 + (c - 128)] = (bf16)f2bf(-x56); GNW[57 * 128 + (c - 128)] = (bf16)f2bf(-x57); GNW[58 * 128 + (c - 128)] = (bf16)f2bf(-x58); GNW[59 * 128 + (c - 128)] = (bf16)f2bf(-x59); GNW[60 * 128 + (c - 128)] = (bf16)f2bf(-x60); GNW[61 * 128 + (c - 128)] = (bf16)f2bf(-x61); GNW[62 * 128 + (c - 128)] = (bf16)f2bf(-x62); GNW[63 * 128 + (c - 128)] = (bf16)f2bf(-x63); }
#undef GDN_RHS
#undef GDN_L4
    } else {
        const int t2 = tid - 256; const float gl = gcs[63];
        { const int i = t2 >> 2, d0 = (t2 & 3) * 32; const float e = __expf(gcs[i]);
#pragma unroll
          for (int x8 = 0; x8 < 4; ++x8) { const v4f a = *(const LAS v4f*)(qs + i * QP + d0 + 8 * x8), b = *(const LAS v4f*)(qs + i * QP + d0 + 8 * x8 + 4);
              v4u w; w.x = pk2(a.x * e, a.y * e); w.y = pk2(a.z * e, a.w * e); w.z = pk2(b.x * e, b.y * e); w.w = pk2(b.z * e, b.w * e); *(v4u*)(GQG + i * 128 + d0 + 8 * x8) = w; } }
        { const int d = t2 >> 1, j0 = (t2 & 1) * 32;
#pragma unroll
          for (int x8 = 0; x8 < 4; ++x8) { float o[8];
#pragma unroll
              for (int x = 0; x < 8; ++x) { const int j = j0 + 8 * x8 + x; o[x] = ks[j * QP + d] * __expf(gl - gcs[j]); }
              v4u w; w.x = pk2(o[0], o[1]); w.y = pk2(o[2], o[3]); w.z = pk2(o[4], o[5]); w.w = pk2(o[6], o[7]); *(v4u*)(GKT + d * 64 + j0 + 8 * x8) = w; } }
        if (t2 == 0) GDL[item] = __expf(gl);
    }
    __syncthreads();
}
struct GdnFrags { bf16x8_t nw[4], qg[4], at[2], kt[2][2]; float u[4]; float dl; };
__device__ __forceinline__ void gdn_load(GdnFrags& F, const Params& p, int item, int off128, int off64, int offk, int offu) {
    const bf16* GNW = (const bf16*)(p.ws + WS_GNW) + (size_t)item * 8192; const bf16* GQG = (const bf16*)(p.ws + WS_GQG) + (size_t)item * 8192;
    const bf16* GAT = (const bf16*)(p.ws + WS_GAT) + (size_t)item * 4096; const bf16* GKT = (const bf16*)(p.ws + WS_GKT) + (size_t)item * 8192; const float* GU = (const float*)(p.ws + WS_GU) + (size_t)item * 8192;
#pragma unroll
    for (int ks = 0; ks < 4; ++ks) { F.nw[ks] = *(const bf16x8_t*)(GNW + off128 + 32 * ks); F.qg[ks] = *(const bf16x8_t*)(GQG + off128 + 32 * ks); }
#pragma unroll
    for (int ks = 0; ks < 2; ++ks) { F.at[ks] = *(const bf16x8_t*)(GAT + off64 + 32 * ks); F.kt[0][ks] = *(const bf16x8_t*)(GKT + offk + 32 * ks); F.kt[1][ks] = *(const bf16x8_t*)(GKT + offk + 1024 + 32 * ks); }
#pragma unroll
    for (int r = 0; r < 4; ++r) F.u[r] = GU[offu + r * 128];
    F.dl = ((const float*)(p.ws + WS_GDL))[item];
}
constexpr int STP = 136, VNP = 72;
__device__ __forceinline__ void gdn_seq(const Params& p, LAS unsigned char* lds, int wgi, int wave, int lane) {
    const int u = wgi * 2 + (wave >> 2), wi = wave & 3, h = u >> 3, sl = u & 7, g = lane >> 4, c = lane & 15;
    LAS unsigned short* ST = (LAS unsigned short*)(lds + (wave >> 2) * 12288);
    LAS unsigned short* VNT = ST + 2 * 16 * STP;
    float* GO = (float*)(p.ws + WS_GO);
    const int off128 = (16 * wi + c) * 128 + 8 * g, off64 = (16 * wi + c) * 64 + 8 * g, offk = (32 * wi + c) * 64 + 8 * g, offu = (16 * wi + 4 * g) * 128 + 16 * sl + c;
#pragma unroll
    for (int mt = 0; mt < 2; ++mt) *(LAS v2u*)(ST + c * STP + 16 * (2 * wi + mt) + 4 * g) = (v2u){0u, 0u};
    pg8::f32x4 Sacc[2] = {{0.f, 0.f, 0.f, 0.f}, {0.f, 0.f, 0.f, 0.f}};
    __syncthreads();
    GdnFrags F0, F1;
    gdn_load(F0, p, h, off128, off64, offk, offu);
#define GDN_STEP(F, n_) do { const int cur = (n_) & 1; bf16x8_t sf[4]; \
        _Pragma("unroll") for (int ks = 0; ks < 4; ++ks) sf[ks] = *(const LAS bf16x8_t*)(ST + cur * 16 * STP + c * STP + 32 * ks + 8 * g); \
        pg8::f32x4 vn = {F.u[0], F.u[1], F.u[2], F.u[3]}; \
        _Pragma("unroll") for (int ks = 0; ks < 4; ++ks) vn = __builtin_amdgcn_mfma_f32_16x16x32_bf16(F.nw[ks], sf[ks], vn, 0, 0, 0); \
        { v2u w; w.x = pk2(vn[0], vn[1]); w.y = pk2(vn[2], vn[3]); *(LAS v2u*)(VNT + c * VNP + 16 * wi + 4 * g) = w; } \
        LDS_BAR(); \
        const bf16x8_t v0 = *(const LAS bf16x8_t*)(VNT + c * VNP + 8 * g), v1 = *(const LAS bf16x8_t*)(VNT + c * VNP + 32 + 8 * g); \
        pg8::f32x4 o = {0.f, 0.f, 0.f, 0.f}; \
        _Pragma("unroll") for (int ks = 0; ks < 4; ++ks) o = __builtin_amdgcn_mfma_f32_16x16x32_bf16(F.qg[ks], sf[ks], o, 0, 0, 0); \
        o = __builtin_amdgcn_mfma_f32_16x16x32_bf16(F.at[0], v0, o, 0, 0, 0); o = __builtin_amdgcn_mfma_f32_16x16x32_bf16(F.at[1], v1, o, 0, 0, 0); \
        { const size_t tb = (size_t)(n_) * 64 + 16 * wi + 4 * g; _Pragma("unroll") for (int r = 0; r < 4; ++r) GO[(tb + r) * BW + h * 128 + 16 * sl + c] = o[r]; } \
        _Pragma("unroll") for (int mt = 0; mt < 2; ++mt) { Sacc[mt] = Sacc[mt] * F.dl; \
            Sacc[mt] = __builtin_amdgcn_mfma_f32_16x16x32_bf16(F.kt[mt][0], v0, Sacc[mt], 0, 0, 0); Sacc[mt] = __builtin_amdgcn_mfma_f32_16x16x32_bf16(F.kt[mt][1], v1, Sacc[mt], 0, 0, 0); \
            v2u w; w.x = pk2(Sacc[mt][0], Sacc[mt][1]); w.y = pk2(Sacc[mt][2], Sacc[mt][3]); *(LAS v2u*)(ST + (cur ^ 1) * 16 * STP + c * STP + 16 * (2 * wi + mt) + 4 * g) = w; } \
        LDS_BAR(); } while (0)
    for (int n = 0; n < T / 64; n += 2) {
        gdn_load(F1, p, (n + 1) * 4 + h, off128, off64, offk, offu);
        GDN_STEP(F0, n);
        gdn_load(F0, p, ((n + 2 < T / 64) ? n + 2 : n) * 4 + h, off128, off64, offk, offu);
        GDN_STEP(F1, n + 1);
    }
#undef GDN_STEP
}

constexpr int SEQ_UOFF = 132096;
constexpr int GI_NW = 0, GI_QG = 8704, GI_AT = 17408, GI_KT = 22016, GI_SZ = 31232;
struct GdnStage { v4u r[7]; float u[4]; float dl; };
__device__ __forceinline__ void gdn_stage_load(GdnStage& Sg, const Params& p, int item, int tid, int offu) {
    const bf16* GNW = (const bf16*)(p.ws + WS_GNW) + (size_t)item * 8192; const bf16* GQG = (const bf16*)(p.ws + WS_GQG) + (size_t)item * 8192;
    const bf16* GAT = (const bf16*)(p.ws + WS_GAT) + (size_t)item * 4096; const bf16* GKT = (const bf16*)(p.ws + WS_GKT) + (size_t)item * 8192; const float* GU = (const float*)(p.ws + WS_GU) + (size_t)item * 8192;
    Sg.r[0] = *(const v4u*)(GNW + 8 * tid); Sg.r[1] = *(const v4u*)(GNW + 8 * (tid + 512)); Sg.r[2] = *(const v4u*)(GQG + 8 * tid); Sg.r[3] = *(const v4u*)(GQG + 8 * (tid + 512));
    Sg.r[4] = *(const v4u*)(GAT + 8 * tid); Sg.r[5] = *(const v4u*)(GKT + 8 * tid); Sg.r[6] = *(const v4u*)(GKT + 8 * (tid + 512));
#pragma unroll
    for (int r = 0; r < 4; ++r) Sg.u[r] = GU[offu + r * 128];
    Sg.dl = ((const float*)(p.ws + WS_GDL))[item];
}
__device__ __forceinline__ void gdn_stage_write(const GdnStage& Sg, LAS unsigned short* img, int tid) {
    { const int p0 = tid, p1 = tid + 512;
      *(LAS v4u*)(img + GI_NW + (p0 >> 4) * 136 + 8 * (p0 & 15)) = Sg.r[0]; *(LAS v4u*)(img + GI_NW + (p1 >> 4) * 136 + 8 * (p1 & 15)) = Sg.r[1];
      *(LAS v4u*)(img + GI_QG + (p0 >> 4) * 136 + 8 * (p0 & 15)) = Sg.r[2]; *(LAS v4u*)(img + GI_QG + (p1 >> 4) * 136 + 8 * (p1 & 15)) = Sg.r[3];
      *(LAS v4u*)(img + GI_AT + (p0 >> 3) * 72 + 8 * (p0 & 7)) = Sg.r[4];
      *(LAS v4u*)(img + GI_KT + (p0 >> 3) * 72 + 8 * (p0 & 7)) = Sg.r[5]; *(LAS v4u*)(img + GI_KT + (p1 >> 3) * 72 + 8 * (p1 & 7)) = Sg.r[6]; }
}
__device__ __forceinline__ void gdn_seq2(const Params& p, LAS unsigned char* lds, int wgi, int tid, int wave, int lane) {
    const int h = wgi >> 2, sl = 2 * (wgi & 3) + (wave >> 2), wi = wave & 3, g = lane >> 4, c = lane & 15;
    LAS unsigned short* IMG = (LAS unsigned short*)lds;
    LAS unsigned short* ST = (LAS unsigned short*)(lds + SEQ_UOFF + (wave >> 2) * 12288);
    LAS unsigned short* VNT = ST + 2 * 16 * STP;
    float* GO = (float*)(p.ws + WS_GO);
    const int offu = (16 * wi + 4 * g) * 128 + 16 * sl + c;
#pragma unroll
    for (int mt = 0; mt < 2; ++mt) *(LAS v2u*)(ST + c * STP + 16 * (2 * wi + mt) + 4 * g) = (v2u){0u, 0u};
    pg8::f32x4 Sacc[2] = {{0.f, 0.f, 0.f, 0.f}, {0.f, 0.f, 0.f, 0.f}};
    GdnStage A, B;
    gdn_stage_load(A, p, h, tid, offu); gdn_stage_write(A, IMG, tid);
    gdn_stage_load(B, p, 4 + h, tid, offu);
    LDS_BAR();
    constexpr int NCH = T / 64;
#define GDN_STEP2(X, Y, n_) do { const int cur = (n_) & 1; const LAS unsigned short* im = IMG + cur * GI_SZ; bf16x8_t sf[4]; \
        _Pragma("unroll") for (int ks = 0; ks < 4; ++ks) sf[ks] = *(const LAS bf16x8_t*)(ST + cur * 16 * STP + c * STP + 32 * ks + 8 * g); \
        pg8::f32x4 vn = {X.u[0], X.u[1], X.u[2], X.u[3]}; const float dl = X.dl; \
        _Pragma("unroll") for (int ks = 0; ks < 4; ++ks) vn = __builtin_amdgcn_mfma_f32_16x16x32_bf16(*(const LAS bf16x8_t*)(im + GI_NW + (16 * wi + c) * 136 + 32 * ks + 8 * g), sf[ks], vn, 0, 0, 0); \
        { v2u w; w.x = pk2(vn[0], vn[1]); w.y = pk2(vn[2], vn[3]); *(LAS v2u*)(VNT + c * VNP + 16 * wi + 4 * g) = w; } \
        pg8::f32x4 o = {0.f, 0.f, 0.f, 0.f}; \
        _Pragma("unroll") for (int ks = 0; ks < 4; ++ks) o = __builtin_amdgcn_mfma_f32_16x16x32_bf16(*(const LAS bf16x8_t*)(im + GI_QG + (16 * wi + c) * 136 + 32 * ks + 8 * g), sf[ks], o, 0, 0, 0); \
        LDS_BAR(); \
        gdn_stage_load(X, p, (((n_) + 2 < NCH) ? (n_) + 2 : (n_)) * 4 + h, tid, offu); \
        const bf16x8_t v0 = *(const LAS bf16x8_t*)(VNT + c * VNP + 8 * g), v1 = *(const LAS bf16x8_t*)(VNT + c * VNP + 32 + 8 * g); \
        o = __builtin_amdgcn_mfma_f32_16x16x32_bf16(*(const LAS bf16x8_t*)(im + GI_AT + (16 * wi + c) * 72 + 8 * g), v0, o, 0, 0, 0); \
        o = __builtin_amdgcn_mfma_f32_16x16x32_bf16(*(const LAS bf16x8_t*)(im + GI_AT + (16 * wi + c) * 72 + 32 + 8 * g), v1, o, 0, 0, 0); \
        { const size_t tb = (size_t)(n_) * 64 + 16 * wi + 4 * g; _Pragma("unroll") for (int r = 0; r < 4; ++r) GO[(tb + r) * BW + h * 128 + 16 * sl + c] = o[r]; } \
        _Pragma("unroll") for (int mt = 0; mt < 2; ++mt) { Sacc[mt] = Sacc[mt] * dl; \
            Sacc[mt] = __builtin_amdgcn_mfma_f32_16x16x32_bf16(*(const LAS bf16x8_t*)(im + GI_KT + (16 * (2 * wi + mt) + c) * 72 + 8 * g), v0, Sacc[mt], 0, 0, 0); \
            Sacc[mt] = __builtin_amdgcn_mfma_f32_16x16x32_bf16(*(const LAS bf16x8_t*)(im + GI_KT + (16 * (2 * wi + mt) + c) * 72 + 32 + 8 * g), v1, Sacc[mt], 0, 0, 0); \
            v2u w; w.x = pk2(Sacc[mt][0], Sacc[mt][1]); w.y = pk2(Sacc[mt][2], Sacc[mt][3]); *(LAS v2u*)(ST + (cur ^ 1) * 16 * STP + c * STP + 16 * (2 * wi + mt) + 4 * g) = w; } \
        gdn_stage_write(Y, IMG + (cur ^ 1) * GI_SZ, tid); \
        LDS_BAR(); } while (0)
    for (int n = 0; n < NCH; n += 2) { GDN_STEP2(A, B, n); GDN_STEP2(B, A, n + 1); }
#undef GDN_STEP2
}
constexpr int MI_Q = 0, MI_S = 4608, MI_K = 9216, MI_SZ = 13824;
struct MlStage { v4u r[3]; bf16x8_t vt[2]; float fl; };
__device__ __forceinline__ void ml_stage_load(MlStage& Sg, const Params& p, int item, int tid, int offV) {
    const bf16* MQ = (const bf16*)(p.ws + WS_MQ) + (size_t)item * 4096; const bf16* MS = (const bf16*)(p.ws + WS_MS) + (size_t)item * 4096; const bf16* MK = (const bf16*)(p.ws + WS_MK) + (size_t)item * 4096;
    const bf16* MV = (const bf16*)(p.ws + WS_MV) + (size_t)item * 9216;
    Sg.r[0] = *(const v4u*)(MQ + 8 * tid); Sg.r[1] = *(const v4u*)(MS + 8 * tid); Sg.r[2] = *(const v4u*)(MK + 8 * tid);
    Sg.vt[0] = *(const bf16x8_t*)(MV + offV); Sg.vt[1] = *(const bf16x8_t*)(MV + offV + 32);
    Sg.fl = ((const float*)(p.ws + WS_MFL))[item];
}
__device__ __forceinline__ void ml_stage_write(const MlStage& Sg, LAS unsigned short* img, int tid) {
    const int o = (tid >> 3) * 72 + 8 * (tid & 7);
    *(LAS v4u*)(img + MI_Q + o) = Sg.r[0]; *(LAS v4u*)(img + MI_S + o) = Sg.r[1]; *(LAS v4u*)(img + MI_K + o) = Sg.r[2];
}
__device__ __forceinline__ void ml_seq2(const Params& p, LAS unsigned char* lds, int wgi, int tid, int wave, int lane) {
    const int h = wgi / 5, sl0 = 2 * (wgi % 5) + (wave >> 2), wi = wave & 3, g = lane >> 4, c = lane & 15;
    const bool real = sl0 < 9; const int sl = real ? sl0 : 8;
    LAS unsigned short* IMG = (LAS unsigned short*)lds;
    LAS unsigned short* CT = (LAS unsigned short*)(lds + SEQ_UOFF + (wave >> 2) * 8192);
    float* HO = (float*)(p.ws + WS_HO); float* HDEN = (float*)(p.ws + WS_HDEN);
    const int offV = (16 * sl + c) * 64 + 8 * g;
    *(LAS v2u*)(CT + c * 72 + 16 * wi + 4 * g) = (v2u){0u, 0u};
    pg8::f32x4 Cacc = {0.f, 0.f, 0.f, 0.f};
    MlStage A, B;
    ml_stage_load(A, p, h, tid, offV); ml_stage_write(A, IMG, tid);
    ml_stage_load(B, p, 4 + h, tid, offV);
    LDS_BAR();
    constexpr int NCH = T / 64;
#define ML_STEP2(X, Y, n_) do { const int cur = (n_) & 1; const LAS unsigned short* im = IMG + cur * MI_SZ; const int ro = (16 * wi + c) * 72 + 8 * g; \
        const bf16x8_t c0 = *(const LAS bf16x8_t*)(CT + cur * 16 * 72 + c * 72 + 8 * g), c1 = *(const LAS bf16x8_t*)(CT + cur * 16 * 72 + c * 72 + 32 + 8 * g); \
        const bf16x8_t vt0 = X.vt[0], vt1 = X.vt[1]; const float fl = X.fl; \
        pg8::f32x4 num = {0.f, 0.f, 0.f, 0.f}; \
        num = __builtin_amdgcn_mfma_f32_16x16x32_bf16(*(const LAS bf16x8_t*)(im + MI_Q + ro), c0, num, 0, 0, 0); num = __builtin_amdgcn_mfma_f32_16x16x32_bf16(*(const LAS bf16x8_t*)(im + MI_Q + ro + 32), c1, num, 0, 0, 0); \
        num = __builtin_amdgcn_mfma_f32_16x16x32_bf16(*(const LAS bf16x8_t*)(im + MI_S + ro), vt0, num, 0, 0, 0); num = __builtin_amdgcn_mfma_f32_16x16x32_bf16(*(const LAS bf16x8_t*)(im + MI_S + ro + 32), vt1, num, 0, 0, 0); \
        Cacc = Cacc * fl; \
        Cacc = __builtin_amdgcn_mfma_f32_16x16x32_bf16(*(const LAS bf16x8_t*)(im + MI_K + ro), vt0, Cacc, 0, 0, 0); Cacc = __builtin_amdgcn_mfma_f32_16x16x32_bf16(*(const LAS bf16x8_t*)(im + MI_K + ro + 32), vt1, Cacc, 0, 0, 0); \
        ml_stage_load(X, p, (((n_) + 2 < NCH) ? (n_) + 2 : (n_)) * 4 + h, tid, offV); \
        { v2u w; w.x = pk2(Cacc[0], Cacc[1]); w.y = pk2(Cacc[2], Cacc[3]); *(LAS v2u*)(CT + (cur ^ 1) * 16 * 72 + c * 72 + 16 * wi + 4 * g) = w; } \
        { const size_t tb = (size_t)(n_) * 64 + 16 * wi + 4 * g; \
          if (sl < 8) { _Pragma("unroll") for (int r = 0; r < 4; ++r) HO[(tb + r) * BW + h * 128 + 16 * sl + c] = num[r]; } \
          else if (c == 0 && real) { _Pragma("unroll") for (int r = 0; r < 4; ++r) HDEN[(tb + r) * 4 + h] = num[r]; } } \
        ml_stage_write(Y, IMG + (cur ^ 1) * MI_SZ, tid); \
        LDS_BAR(); } while (0)
    for (int n = 0; n < NCH; n += 2) { ML_STEP2(A, B, n); ML_STEP2(B, A, n + 1); }
#undef ML_STEP2
}

__device__ __forceinline__ void mixer_gmlp_item(const Params& p, int l, LAS unsigned char* lds, int item, int tid, int wave, int lane) {
    const int chunk = item >> 2, g = item & 3; const size_t tok0 = (size_t)chunk * 128;
    const bf16* Z = (const bf16*)(p.ws + WS_Z); bf16* BR1 = (bf16*)(p.ws + WS_BR) + 1 * BW;
    const float* ng = p.in[I_GMNG] + l * BW; const float* nb = p.in[I_GMNB] + l * BW;
    const float* wsp = p.in[I_GMWS] + ((size_t)(l * 4 + g) * 128) * 128; const float* bsp = p.in[I_GMBS] + (l * 4 + g) * 128;
    LAS float* vn = (LAS float*)lds;
    for (int r = 0; r < 16; ++r) { const int tk = wave * 16 + r;
        const v4u raw = *(const v4u*)(Z + (tok0 + tk) * ZC + ZC_GMV + 8 * lane); float x[8]; unpack8(raw, x); float s = 0.f;
#pragma unroll
        for (int i = 0; i < 8; ++i) { x[i] = gelu_tanh(x[i]); s += x[i]; }
        const float mean = wave_sum(s) * (1.f / 512.f); float ss = 0.f;
#pragma unroll
        for (int i = 0; i < 8; ++i) { x[i] -= mean; ss += x[i] * x[i]; }
        const float rstd = rsqrtf(wave_sum(ss) * (1.f / 512.f) + LN_EPS);
        if ((lane >> 4) == g) { const int cl = 8 * (lane & 15);
#pragma unroll
            for (int i = 0; i < 8; ++i) vn[tk * 128 + cl + i] = x[i] * rstd * ng[8 * lane + i] + nb[8 * lane + i]; }
    }
    __syncthreads();
    const int t = tid >> 2, cq = tid & 3; float acc[32];
#pragma unroll
    for (int i = 0; i < 32; ++i) acc[i] = 0.f;
    const float* wrow = wsp + (size_t)t * 128;
    for (int s = 0; s <= t; ++s) { const float w = wrow[s]; const LAS float* row = vn + s * 128 + cq * 32;
#pragma unroll
        for (int i4 = 0; i4 < 8; ++i4) { const v4f a = *(const LAS v4f*)(row + 4 * i4); acc[4 * i4] += w * a.x; acc[4 * i4 + 1] += w * a.y; acc[4 * i4 + 2] += w * a.z; acc[4 * i4 + 3] += w * a.w; } }
    const float bias = bsp[t];
#pragma unroll
    for (int i8 = 0; i8 < 4; ++i8) { const v4u raw = *(const v4u*)(Z + (tok0 + t) * ZC + ZC_GMU + g * 128 + cq * 32 + 8 * i8); float u[8]; unpack8(raw, u); float o[8];
#pragma unroll
        for (int i = 0; i < 8; ++i) o[i] = gelu_tanh(u[i]) * (acc[8 * i8 + i] + bias);
#if MERGE_FP8
        *(v2u*)((unsigned char*)(p.ws + WS_BR) + (tok0 + t) * BRW + 1 * BW + g * 128 + cq * 32 + 8 * i8) = (v2u){pk4_f8(o[0], o[1], o[2], o[3], BRSC), pk4_f8(o[4], o[5], o[6], o[7], BRSC)}; }
#else
        v4u w; w.x = pk2(o[0], o[1]); w.y = pk2(o[2], o[3]); w.z = pk2(o[4], o[5]); w.w = pk2(o[6], o[7]);
        *(v4u*)(BR1 + (tok0 + t) * BRW + g * 128 + cq * 32 + 8 * i8) = w; }
#endif
    __syncthreads();
}

__device__ __forceinline__ void vt_item(const Params& p, LAS unsigned char* lds, int item, int tid) {
    const int h = item & 3, n = item >> 2; const size_t t0 = (size_t)n * 64;
    const bf16* Z = (const bf16*)(p.ws + WS_Z); bf16* VT = (bf16*)(p.ws + WS_VT);
    LAS unsigned short* vs = (LAS unsigned short*)lds;
#pragma unroll
    for (int r = 0; r < 2; ++r) { const int idx = tid + 512 * r, tk = idx >> 4, c8 = idx & 15;
        *(LAS v4u*)(vs + tk * 136 + 8 * c8) = *(const v4u*)(Z + (t0 + tk) * ZC + ZC_SBV + h * 128 + 8 * c8); }
    __syncthreads();
    { const int d = tid >> 2, jq = tid & 3; unsigned w[8];
#pragma unroll
      for (int x = 0; x < 8; ++x) w[x] = (unsigned)vs[(16 * jq + 2 * x) * 136 + d] | ((unsigned)vs[(16 * jq + 2 * x + 1) * 136 + d] << 16);
      bf16* dst = VT + ((size_t)h * 128 + d) * T + t0 + 16 * jq;
      *(v4u*)dst = (v4u){w[0], w[1], w[2], w[3]}; *(v4u*)(dst + 8) = (v4u){w[4], w[5], w[6], w[7]}; }
    __syncthreads();
}
constexpr int KTP = 136, VTP = 72;
__device__ __forceinline__ void sb_unit(const Params& p, LAS unsigned char* lds, int unit, int tid, int wave, int lane) {
    const int h = unit >> 6, q0 = (unit & 63) * 128, g = lane >> 4, c = lane & 15; const int qrow = q0 + 16 * wave + c;
    const bf16* Z = (const bf16*)(p.ws + WS_Z); const bf16* VT = (const bf16*)(p.ws + WS_VT) + (size_t)h * 128 * T; bf16* BR0 = (bf16*)(p.ws + WS_BR);
    LAS unsigned short* Kt = (LAS unsigned short*)lds;
    LAS unsigned short* Vt = Kt + 2 * 64 * KTP;
    LAS int* flags = (LAS int*)(Vt + 2 * 128 * VTP);
    bf16x8_t qf[4];
#pragma unroll
    for (int ks = 0; ks < 4; ++ks) qf[ks] = *(const bf16x8_t*)(Z + (size_t)qrow * ZC + ZC_SBQ + h * 128 + 32 * ks + 8 * g);
    pg8::f32x4 acc[8];
#pragma unroll
    for (int dt = 0; dt < 8; ++dt) acc[dt] = (pg8::f32x4){0.f, 0.f, 0.f, 0.f};
    float racc = 0.f;
    v4u kr[2], vr[2];
    const int jt = (q0 >> 6) + 1;
#define SB_GLOAD(j_) do { _Pragma("unroll") for (int r = 0; r < 2; ++r) { const int idx = tid + 512 * r; \
        kr[r] = *(const v4u*)(Z + (size_t)(64 * (j_) + (idx >> 4)) * ZC + ZC_SBK + h * 128 + 8 * (idx & 15)); \
        vr[r] = *(const v4u*)(VT + (size_t)(idx >> 3) * T + 64 * (j_) + 8 * (idx & 7)); } } while (0)
#define SB_LWRITE(b_) do { _Pragma("unroll") for (int r = 0; r < 2; ++r) { const int idx = tid + 512 * r; \
        *(LAS v4u*)(Kt + (b_) * 64 * KTP + (idx >> 4) * KTP + 8 * (idx & 15)) = kr[r]; *(LAS v4u*)(Vt + (b_) * 128 * VTP + (idx >> 3) * VTP + 8 * (idx & 7)) = vr[r]; } } while (0)
    LDS_BAR();
    SB_GLOAD(jt); SB_LWRITE(0);
    LDS_BAR();
    for (int j = jt, it = 0; j >= 0; --j, ++it) {
        const int cur = it & 1;
        SB_GLOAD(j > 0 ? j - 1 : 0);
        const bool wdone = __all(racc > 104.f);
        if (64 * j < q0 + 16 * wave + 15 && !wdone) {
            const LAS unsigned short* Kc = Kt + cur * 64 * KTP; const LAS unsigned short* Vc = Vt + cur * 128 * VTP;
            pg8::f32x4 z[4];
#pragma unroll
            for (int s = 0; s < 4; ++s) { z[s] = (pg8::f32x4){0.f, 0.f, 0.f, 0.f};
#pragma unroll
                for (int ks = 0; ks < 4; ++ks) z[s] = __builtin_amdgcn_mfma_f32_16x16x32_bf16(*(const LAS bf16x8_t*)(Kc + (16 * s + c) * KTP + 32 * ks + 8 * g), qf[ks], z[s], 0, 0, 0); }
            float sp[4][4], t[4], xs[4]; bool mk[4][4];
#pragma unroll
            for (int s = 0; s < 4; ++s) { t[s] = 0.f;
#pragma unroll
                for (int r = 0; r < 4; ++r) { const int key = 64 * j + 16 * s + 4 * g + r; mk[s][r] = key < qrow; const float zz = z[s][r] * 0.08838834764831845f; z[s][r] = zz;
                    sp[s][r] = mk[s][r] ? softplusf_(zz) : 0.f; t[s] += sp[s][r]; } }
            float grand = 0.f, higher[4];
#pragma unroll
            for (int s = 3; s >= 0; --s) { float x = t[s]; float y = __shfl(x, lane + 16); x += (g < 3) ? y : 0.f; y = __shfl(x, lane + 32); x += (g < 2) ? y : 0.f;
                xs[s] = x - t[s];
                const float tot = __shfl(x, c); higher[s] = grand; grand += tot; }
            bf16x8_t pf[2];
#pragma unroll
            for (int s = 0; s < 4; ++s) { float a[4]; float e = 0.f;
#pragma unroll
                for (int r = 3; r >= 0; --r) { const float la = z[s][r] - sp[s][r] - (racc + higher[s] + xs[s] + e); a[r] = mk[s][r] ? __expf(la) : 0.f; e += sp[s][r]; }
                const unsigned w0 = pk2(a[0], a[1]), w1 = pk2(a[2], a[3]);
                if ((s & 1) == 0) { pf[s >> 1][0] = (short)(w0 & 0xffff); pf[s >> 1][1] = (short)(w0 >> 16); pf[s >> 1][2] = (short)(w1 & 0xffff); pf[s >> 1][3] = (short)(w1 >> 16); }
                else              { pf[s >> 1][4] = (short)(w0 & 0xffff); pf[s >> 1][5] = (short)(w0 >> 16); pf[s >> 1][6] = (short)(w1 & 0xffff); pf[s >> 1][7] = (short)(w1 >> 16); } }
            racc += grand;
#pragma unroll
            for (int dt = 0; dt < 8; ++dt)
#pragma unroll
                for (int k2 = 0; k2 < 2; ++k2) { const v2u lo = *(const LAS v2u*)(Vc + (16 * dt + c) * VTP + 32 * k2 + 4 * g), hi = *(const LAS v2u*)(Vc + (16 * dt + c) * VTP + 32 * k2 + 16 + 4 * g);
                    const v4u vv = (v4u){lo.x, lo.y, hi.x, hi.y};
                    acc[dt] = __builtin_amdgcn_mfma_f32_16x16x32_bf16(__builtin_bit_cast(bf16x8_t, vv), pf[k2], acc[dt], 0, 0, 0); }
        }
        const bool wd2 = __all(racc > 104.f);
        if (lane == 0) flags[cur * 8 + wave] = wd2 ? 1 : 0;
        SB_LWRITE(cur ^ 1);
        LDS_BAR();
        int alld = 1;
#pragma unroll
        for (int w = 0; w < 8; ++w) alld &= flags[cur * 8 + w];
        if (alld) break;
    }
#undef SB_GLOAD
#undef SB_LWRITE
#pragma unroll
#if MERGE_FP8
    for (int dt = 0; dt < 8; ++dt) *(unsigned*)((unsigned char*)BR0 + (size_t)qrow * BRW + h * 128 + 16 * dt + 4 * g) = pk4_f8(acc[dt][0], acc[dt][1], acc[dt][2], acc[dt][3], BRSC);
#else
    for (int dt = 0; dt < 8; ++dt) { v2u w; w.x = pk2(acc[dt][0], acc[dt][1]); w.y = pk2(acc[dt][2], acc[dt][3]); *(v2u*)(BR0 + (size_t)qrow * BRW + h * 128 + 16 * dt + 4 * g) = w; }
#endif
}

__device__ __forceinline__ void phase_mixers(const Params& p, int l, LAS unsigned char* lds, int wg, int G, int tid, int wave, int lane, const XcdBarrier& bar) {
#if defined(PROBE_SPLIT)
    if (wg < 16) gdn_seq2(p, lds, wg, tid, wave, lane); else if (wg < 36) ml_seq2(p, lds, wg - 16, tid, wave, lane);
    xcd_barrier(bar);
    const int w2 = wg, G2 = G;
#else
    if (wg < 16) { gdn_seq2(p, lds, wg, tid, wave, lane); return; }
    if (wg < 36) { ml_seq2(p, lds, wg - 16, tid, wave, lane); return; }
    const int w2 = wg - 36, G2 = G - 36;
#endif
    for (int it = w2; it < 256; it += G2) mixer_gmlp_item(p, l, lds, it, tid, wave, lane);
    for (int it = w2; it < 256; it += G2) sb_unit(p, lds, it, tid, wave, lane);
#if !defined(PROBE_CONV0)
    __syncthreads();
#if defined(PROBE_CONVDUP)
#pragma nounroll
    for (int rep = 0; rep < 2; ++rep)
#endif
    phase_convert<1>(p, l, lds, w2 * 8 + wave, G2 * 8, wave, lane
#if defined(PROBE_CONVDUP)
        , (PROBE_CONVDUP == 2) && rep == 1
#endif
        );
#endif
}

__device__ __forceinline__ void phase_post(const Params& p, int l, int gw, int NGW, int lane) {
    const bf16* Z = (const bf16*)(p.ws + WS_Z); const float* GO = (const float*)(p.ws + WS_GO); const float* HO = (const float*)(p.ws + WS_HO); const float* HDEN = (const float*)(p.ws + WS_HDEN);
    bf16* BR2 = (bf16*)(p.ws + WS_BR) + 2 * BW; bf16* BR3 = (bf16*)(p.ws + WS_BR) + 3 * BW;
    const float* gng = p.in[I_GDNNG] + l * 128; const float* mng = p.in[I_MLNG] + l * BW;
    for (int t = gw; t < T; t += NGW) {
        {   const v4f a0 = *(const v4f*)(GO + (size_t)t * BW + 8 * lane), a1 = *(const v4f*)(GO + (size_t)t * BW + 8 * lane + 4); float o[8] = {a0.x, a0.y, a0.z, a0.w, a1.x, a1.y, a1.z, a1.w}; float ss = 0.f;
#pragma unroll
            for (int i = 0; i < 8; ++i) ss += o[i] * o[i];
            const float r = rsqrtf(sum16(ss) * (1.f / 128.f) + LN_EPS);
            const v4u graw = *(const v4u*)(Z + (size_t)t * ZC + ZC_GDNG + 8 * lane); float gt[8]; unpack8(graw, gt);
#pragma unroll
            for (int i = 0; i < 8; ++i) o[i] = o[i] * r * gng[(8 * lane + i) & 127] * siluf_(gt[i]);
#if MERGE_FP8
            *(v2u*)((unsigned char*)(p.ws + WS_BR) + (size_t)t * BRW + 2 * BW + 8 * lane) = (v2u){pk4_f8(o[0], o[1], o[2], o[3], BRSC), pk4_f8(o[4], o[5], o[6], o[7], BRSC)}; }
#else
            v4u w; w.x = pk2(o[0], o[1]); w.y = pk2(o[2], o[3]); w.z = pk2(o[4], o[5]); w.w = pk2(o[6], o[7]); *(v4u*)(BR2 + (size_t)t * BRW + 8 * lane) = w; }
#endif
        {   const v4f a0 = *(const v4f*)(HO + (size_t)t * BW + 8 * lane), a1 = *(const v4f*)(HO + (size_t)t * BW + 8 * lane + 4); float o[8] = {a0.x, a0.y, a0.z, a0.w, a1.x, a1.y, a1.z, a1.w}; float ss = 0.f;
            const float dn = 1.f / fmaxf(fabsf(HDEN[(size_t)t * 4 + (lane >> 4)]), 1.f);
#pragma unroll
            for (int i = 0; i < 8; ++i) { o[i] *= dn; ss += o[i] * o[i]; }
            const float r = rsqrtf(sum16(ss) * (1.f / 128.f) + LN_EPS);
            const v4u graw = *(const v4u*)(Z + (size_t)t * ZC + ZC_MLO + 8 * lane); float gt[8]; unpack8(graw, gt);
#pragma unroll
            for (int i = 0; i < 8; ++i) o[i] = o[i] * r * mng[8 * lane + i] * sigmoidf_(gt[i]);
#if MERGE_FP8
            *(v2u*)((unsigned char*)(p.ws + WS_BR) + (size_t)t * BRW + 3 * BW + 8 * lane) = (v2u){pk4_f8(o[0], o[1], o[2], o[3], BRSC), pk4_f8(o[4], o[5], o[6], o[7], BRSC)}; }
#else
            v4u w; w.x = pk2(o[0], o[1]); w.y = pk2(o[2], o[3]); w.z = pk2(o[4], o[5]); w.w = pk2(o[6], o[7]); *(v4u*)(BR3 + (size_t)t * BRW + 8 * lane) = w; }
#endif
    }
}

__device__ __forceinline__ void ln_row(const float* yrow, const float* g, const float* b, int lane, v4f (&v)[8]) {
    const v4f* yr = (const v4f*)yrow + lane; float s = 0.f;
#pragma unroll
    for (int j = 0; j < 8; ++j) { v[j] = yr[64 * j]; s += (v[j].x + v[j].y) + (v[j].z + v[j].w); }
    const float mean = wave_sum(s) * (1.f / D); float s2 = 0.f;
#pragma unroll
    for (int j = 0; j < 8; ++j) { v[j] = v[j] - mean; s2 += (v[j].x * v[j].x + v[j].y * v[j].y) + (v[j].z * v[j].z + v[j].w * v[j].w); }
    const float rstd = rsqrtf(wave_sum(s2) * (1.f / D) + LN_EPS);
#pragma unroll
    for (int j = 0; j < 8; ++j) { const v4f gg = ((const v4f*)g)[lane + 64 * j], bb = ((const v4f*)b)[lane + 64 * j]; v[j] = v[j] * rstd * gg + bb; }
}
constexpr int RT_XP = 2052;
constexpr int RT_TAB = 131072 + 1024;
__device__ __forceinline__ void phase_ln1_router(const Params& p, int l, LAS unsigned char* lds, int wg, int G, int wave, int lane, int cnt_shift = 0) {
    const bf16* Y = (const bf16*)(p.ws + WS_Y); bf16* X1 = (bf16*)(p.ws + WS_X1); bf16* X1B = (bf16*)(p.ws + WS_X1B); int* LIST = (int*)(p.ws + WS_LIST); float* WL = (float*)(p.ws + WS_WL); unsigned* SLOT = (unsigned*)(p.ws + WS_SLOT);
    unsigned* cnt = (unsigned*)(p.ws + WS_CTL) + CW_CNT + l * 4096 + cnt_shift;
    const float* g1 = p.in[I_LN1G] + (size_t)l * D; const float* b1 = p.in[I_LN1B] + (size_t)l * D;
    const float* wr = p.in[I_WR] + (size_t)l * D * NE; const float rbias = p.in[I_RB][l * NE + lane];
    LAS float* xt = (LAS float*)lds;
    LAS float* part = (LAS float*)lds;
    LAS unsigned char* selm = lds + RT_TAB; LAS unsigned char* rkm = selm + 4096; LAS float* wtm = (LAS float*)(rkm + 4096); LAS unsigned* basem = (LAS unsigned*)(wtm + 4096);
    const int n_l = lane & 15, kq = lane >> 4;
    int gi = 0;
    for (int tg = wg; tg < T / 16; tg += G, ++gi) {
        {   v4f va[8], vb[8]; const size_t m0 = (size_t)tg * 16 + 2 * wave;
#pragma unroll
            for (int j = 0; j < 8; ++j) { va[j] = ld4(Y, m0 * D + 4 * lane + 256 * j, true); vb[j] = ld4(Y, (m0 + 1) * D + 4 * lane + 256 * j, true); }
            float sa = 0.f, sb = 0.f;
#pragma unroll
            for (int j = 0; j < 8; ++j) { sa += (va[j].x + va[j].y) + (va[j].z + va[j].w); sb += (vb[j].x + vb[j].y) + (vb[j].z + vb[j].w); }
            const float ma = wave_sum(sa) * (1.f / D), mb = wave_sum(sb) * (1.f / D); float qa = 0.f, qb = 0.f;
#pragma unroll
            for (int j = 0; j < 8; ++j) { va[j] = va[j] - ma; vb[j] = vb[j] - mb; qa += (va[j].x * va[j].x + va[j].y * va[j].y) + (va[j].z * va[j].z + va[j].w * va[j].w); qb += (vb[j].x * vb[j].x + vb[j].y * vb[j].y) + (vb[j].z * vb[j].z + vb[j].w * vb[j].w); }
            const float ra = rsqrtf(wave_sum(qa) * (1.f / D) + LN_EPS), rb = rsqrtf(wave_sum(qb) * (1.f / D) + LN_EPS);
#pragma unroll
            for (int j = 0; j < 8; ++j) { const v4f gg = ((const v4f*)g1)[lane + 64 * j], bb = ((const v4f*)b1)[lane + 64 * j]; va[j] = va[j] * ra * gg + bb; vb[j] = vb[j] * rb * gg + bb; }
#pragma unroll
            for (int rr = 0; rr < 2; ++rr) { const size_t m = m0 + rr; v2u* xo = (v2u*)(X1 + m * D) + lane;
#pragma unroll
                for (int j = 0; j < 8; ++j) { const v4f v = rr ? vb[j] : va[j]; xo[64 * j] = (v2u){pk2(v.x, v.y), pk2(v.z, v.w)};
#if MOE_UP_FP8
                    { unsigned w = 0; w = __builtin_amdgcn_cvt_pk_fp8_f32(v.x, v.y, w, false); w = __builtin_amdgcn_cvt_pk_fp8_f32(v.z, v.w, w, true); ((unsigned*)((unsigned char*)X1B + m * D))[lane + 64 * j] = w; }
#else
                    { v2u o; o.x = pk2(v.x, v.y); o.y = pk2(v.z, v.w); ((v2u*)(X1B + m * D))[lane + 64 * j] = o; }
#endif
                    *(LAS v4f*)(xt + (2 * wave + rr) * RT_XP + 4 * lane + 256 * j) = v; } } }
        __syncthreads();
        {   pg8::f32x4 acc[4];
#pragma unroll
            for (int i = 0; i < 4; ++i) acc[i] = (pg8::f32x4){0.f, 0.f, 0.f, 0.f};
            const float* wb = wr + (size_t)(256 * wave + 4 * kq) * NE + 4 * n_l;
            const LAS float* xa = xt + n_l * RT_XP + 256 * wave + 4 * kq;
            v4f bwa[16], bwb[16];
#define RT_LOADW(dst, sb_) do { _Pragma("unroll") for (int q = 0; q < 16; ++q) dst[q] = *(const v4f*)(wb + (size_t)(16 * (4 * (sb_) + (q >> 2)) + (q & 3)) * NE); } while (0)
#define RT_MMA(src, sb_) do { _Pragma("unroll") for (int sg = 0; sg < 4; ++sg) { const v4f a4 = *(const LAS v4f*)(xa + 16 * (4 * (sb_) + sg)); \
                _Pragma("unroll") for (int c = 0; c < 4; ++c) { const v4f b4 = src[sg * 4 + c]; const float a = c == 0 ? a4.x : c == 1 ? a4.y : c == 2 ? a4.z : a4.w; \
                    acc[0] = __builtin_amdgcn_mfma_f32_16x16x4f32(a, b4.x, acc[0], 0, 0, 0); acc[1] = __builtin_amdgcn_mfma_f32_16x16x4f32(a, b4.y, acc[1], 0, 0, 0); \
                    acc[2] = __builtin_amdgcn_mfma_f32_16x16x4f32(a, b4.z, acc[2], 0, 0, 0); acc[3] = __builtin_amdgcn_mfma_f32_16x16x4f32(a, b4.w, acc[3], 0, 0, 0); } } } while (0)
            RT_LOADW(bwa, 0);
#pragma unroll 1
            for (int h = 0; h < 2; ++h) {
                RT_LOADW(bwb, 1); RT_MMA(bwa, 0);
                if (h == 0) RT_LOADW(bwa, 2);
                RT_MMA(bwb, 1);
                wb += (size_t)128 * NE; xa += 128; asm volatile("" : "+v"(wb));
            }
#undef RT_LOADW
#undef RT_MMA
            __syncthreads();
#pragma unroll
            for (int j = 0; j < 4; ++j) *(LAS v4f*)(part + (wave * 16 + 4 * kq + j) * 64 + 4 * n_l) = (v4f){acc[0][j], acc[1][j], acc[2][j], acc[3][j]}; }
        __syncthreads();
#pragma unroll 1
        for (int rr = 0; rr < 2; ++rr) { const int lr = wave + 8 * rr; float logit = 0.f;
#pragma unroll
            for (int w = 0; w < 8; ++w) logit += part[(w * 16 + lr) * 64 + lane];
            const float s = sigmoidf_(logit), biased = s + rbias;
            const float m1 = max8(biased); const float li = (float)(lane & 7);
            const float first = min8(biased == m1 ? li : 8.f);
            const float m2 = max8(li == first ? -INFINITY : biased);
            const float gs = m1 + m2; const int myg = lane >> 3; int grank = 0;
#pragma unroll
            for (int g2 = 0; g2 < 8; ++g2) { const float o = __builtin_bit_cast(float, __builtin_amdgcn_readlane(__builtin_bit_cast(int, gs), g2 * 8)); grank += (o > gs || (o == gs && g2 < myg)) ? 1 : 0; }
            const float masked = grank < 4 ? biased : -INFINITY; int rank = 0;
#pragma unroll
            for (int e2 = 0; e2 < 64; ++e2) { const float o = __builtin_bit_cast(float, __builtin_amdgcn_readlane(__builtin_bit_cast(int, masked), e2)); rank += (o > masked || (o == masked && e2 < lane)) ? 1 : 0; }
            const float wsel = rank < 6 ? s : 0.f; const float tot = wave_sum(wsel);
            const int ri = gi * 16 + lr;
            selm[ri * 64 + lane] = (rank < 6) ? 1 : 0; rkm[ri * 64 + lane] = (unsigned char)rank; wtm[ri * 64 + lane] = wsel / tot * 2.5f; }
        __syncthreads();
    }
    const int nrows = gi * 16;
    if (wave == 0) { unsigned n = 0;
        for (int r = 0; r < nrows; ++r) n += selm[r * 64 + lane];
        unsigned base = 0; if (n && !(PROBE_NOATOM && cnt_shift)) base = __hip_atomic_fetch_add(cnt + 64 * lane, n, __ATOMIC_RELAXED, __HIP_MEMORY_SCOPE_AGENT);
        basem[lane] = base; }
    __syncthreads();
    for (int ri = wave; ri < nrows; ri += 8) { unsigned pos = basem[lane];
        for (int r = 0; r < ri; ++r) pos += selm[r * 64 + lane];
        if (selm[ri * 64 + lane]) { const size_t m = (size_t)(wg + (ri >> 4) * G) * 16 + (ri & 15); const int rk = rkm[ri * 64 + lane];
            LIST[lane * T + pos] = (int)m; WL[lane * T + pos] = wtm[ri * 64 + lane]; SLOT[m * 8 + rk] = ((unsigned)lane << 16) | pos; } }
    __syncthreads();
}
__device__ __forceinline__ void phase_combine_ln2(const Params& p, int l, void* dst, bool dbf, int gw, int NGW, int lane) {
    const bf16* X1 = (const bf16*)(p.ws + WS_X1); const bf16* YE = (const bf16*)(p.ws + WS_YEXP); const unsigned* SLOT = (const unsigned*)(p.ws + WS_SLOT);
    const unsigned* cnt = (const unsigned*)(p.ws + WS_CTL) + CW_CNT + l * 4096;
    const float* g2 = p.in[I_LN2G] + (size_t)l * D; const float* b2 = p.in[I_LN2B] + (size_t)l * D;
    const int tiles = ((int)cnt[64 * lane] + 255) >> 8; const float incl = wave_scan_incl((float)tiles);
    const int toff = (int)incl - tiles;
    const int tsh = __builtin_amdgcn_readlane((int)incl, 63);
    for (int m = gw; m < T; m += NGW) {
        v4f v[8];
#pragma unroll
        for (int j = 0; j < 8; ++j) v[j] = ld4(X1, (size_t)m * D + 4 * lane + 256 * j, true) * ALPHA;
#pragma unroll
        for (int k = 0; k < 7; ++k) { size_t row;
            if (k == 0) row = (size_t)tsh * 256 + m;
            else { const unsigned s = __builtin_amdgcn_readfirstlane(SLOT[(size_t)m * 8 + (k - 1)]); const int e = (int)(s >> 16); row = (size_t)__builtin_amdgcn_readlane(toff, e) * 256 + (s & 0xffffu); }
            const v2u* yr = (const v2u*)(YE + row * D) + lane;
#pragma unroll
            for (int j = 0; j < 8; ++j) { const v2u y = yr[64 * j]; v[j].x += bflo(y.x); v[j].y += bfhi(y.x); v[j].z += bflo(y.y); v[j].w += bfhi(y.y); } }
        float s = 0.f;
#pragma unroll
        for (int j = 0; j < 8; ++j) s += (v[j].x + v[j].y) + (v[j].z + v[j].w);
        const float mean = wave_sum(s) * (1.f / D); float s2 = 0.f;
#pragma unroll
        for (int j = 0; j < 8; ++j) { v[j] = v[j] - mean; s2 += (v[j].x * v[j].x + v[j].y * v[j].y) + (v[j].z * v[j].z + v[j].w * v[j].w); }
        const float rstd = rsqrtf(wave_sum(s2) * (1.f / D) + LN_EPS);
#pragma unroll
        for (int j = 0; j < 8; ++j) { const v4f gg = ((const v4f*)g2)[lane + 64 * j], bb = ((const v4f*)b2)[lane + 64 * j]; const v4f o = v[j] * rstd * gg + bb;
            if (dbf) ((v2u*)((bf16*)dst + (size_t)m * D))[lane + 64 * j] = (v2u){pk2(o.x, o.y), pk2(o.z, o.w)};
            else ((v4f*)((float*)dst + (size_t)m * D))[lane + 64 * j] = o; }
    }
}

constexpr int NPH = 11;
template <class S> struct DupOrder {
    S s; int n;
    __device__ __forceinline__ bool next(int i, Unit& u) const { return s.next(i >= n ? i - n : i, u); }
    __device__ __forceinline__ int row_token(int i, int r) const { return s.row_token(i >= n ? i - n : i, r); }
    __device__ __forceinline__ void a_ready(const Unit& u) const { s.a_ready(u); }
    __device__ __forceinline__ void done(const Unit& u) const { s.done(u); }
};
template <class S> __device__ __forceinline__ int count_units(const S& s) { Unit u; int n = 0; while (n < 64 && s.next(n, u)) ++n; return n; }
#define ORDER_T(k, T) typename std::conditional<PROBE_DUP == (k), DupOrder<T>, T>::type
template <class S> __device__ __forceinline__ DupOrder<S> make_order(const S& s, std::true_type) { DupOrder<S> d{s, count_units(s)}; d.n = count_units(s); return d; }
template <class S> __device__ __forceinline__ S make_order(const S& s, std::false_type) { return s; }
#define MAKE_ORDER(k, s) make_order(s, std::integral_constant<bool, PROBE_DUP == (k)>())
template <int l>
__device__ __forceinline__ void run_layer(const Params& p, LAS unsigned char* lds, const XcdBarrier& bar, int tid, int lane, int wave, int G, int wg, int gw, int NGW) {
    unsigned char* ws = p.ws;
    {
        const void* xin = (l == 0) ? (const void*)p.in[I_X] : (const void*)(ws + WS_XCUR);
        void* xout = (l == NL - 1) ? (void*)p.out : (void*)(ws + WS_XCUR);
#ifndef PROBE_DUP
#define PROBE_DUP (-1)
#endif
#define IS_GEMM_PH(k) ((k) == 1 || (k) == 5 || (k) == 6 || (k) == 8 || (k) == 9)
#define REP(k) _Pragma("nounroll") for (int _r = 0; _r < ((PROBE_DUP == (k) && !IS_GEMM_PH(k)) ? 2 + (p.ph_lo >> 20) : 1); ++_r)
#ifndef PH_MASK
#define PH_MASK 0x7ff
#endif
#define RUN(k) (((PH_MASK >> (k)) & 1) && p.ph_lo <= l * NPH + (k) && l * NPH + (k) < p.ph_hi)
#define SEAM(k) do { if (l * NPH + (k) + 1 < p.ph_hi) xcd_barrier(bar); } while (0)
        if (RUN(0)) { REP(0) { phase_convert<0>(p, l, lds, gw, NGW, wave, lane);
#if defined(PROBE_CONV0)
            phase_convert<1>(p, l, lds, gw, NGW, wave, lane);
#endif
 phase_xprep(p, l, xin, l > 0, lds, gw, NGW, tid, lane); } SEAM(0); }
        if (RUN(1)) { REP(1) { pg8::Gemm g{(const bf16*)(ws + WS_XB), (const bf16*)(ws + WS_WIN), T, ZC, D / 2, D / 2, D / 2}; pg8::StaticOrder S; S.init(T, ZC, G, wg);
            pg8::EpiBf16<0> E{(bf16*)(ws + WS_Z), ZC, nullptr, 0, 0, 1.f / 64.f};
            auto S2 = MAKE_ORDER(1, S); pg8::gemm_phase<pg8::EpiBf16<0>, ORDER_T(1, pg8::StaticOrder), true, true, true>(lds, g, S2, E); } SEAM(1); }
        if (RUN(2)) { REP(2) { for (int it = wg; it < 1536; it += G) { if (it < 512) gdn_pre_item(p, l, lds, it, tid, wave, lane); else if (it < 1024) ml_pre_item(p, l, lds, it - 512, tid, wave, lane); else vt_item(p, lds, it - 1024, tid); } } SEAM(2); }
        if (RUN(3)) { REP(3) { phase_mixers(p, l, lds, wg, G, tid, wave, lane, bar); } SEAM(3); }
        if (RUN(4)) { REP(4) { phase_post(p, l, gw, NGW, lane); } SEAM(4); }
        if (RUN(5)) { REP(5) { constexpr int KM = MERGE_FP8 ? BRW / 2 : BRW; pg8::Gemm g{(const bf16*)(ws + WS_BR), (const bf16*)(ws + WS_WBR), T, D, KM, KM, KM}; pg8::StaticOrder S; S.init(T, D, G, wg);
            EpiMergeH E{(const bf16*)(ws + WS_Z), (bf16*)(ws + WS_MSUM)};
            auto S2 = MAKE_ORDER(5, S); pg8::gemm_phase<EpiMergeH, ORDER_T(5, pg8::StaticOrder), true, true, MERGE_FP8 != 0>(lds, g, S2, E); } SEAM(5); }
        if (RUN(6)) { REP(6) { pg8::Gemm g{(const bf16*)(ws + WS_MSUM), (const bf16*)(ws + WS_WOUT), T, D, D / 2, D / 2, D / 2}; pg8::StaticOrder S; S.init(T, D, G, wg);
            EpiResid E{xin, (bf16*)(ws + WS_Y), 1.f / 64.f, l > 0};
            auto S2 = MAKE_ORDER(6, S); pg8::gemm_phase<EpiResid, ORDER_T(6, pg8::StaticOrder), true, true, true>(lds, g, S2, E); } SEAM(6); }
        if (RUN(7)) { REP(7) { phase_ln1_router(p, l, lds, wg, G, wave, lane, (PROBE_DUP == 7 && _r == 0) ? 16384 : 0); } SEAM(7); }
        if (RUN(8)) { REP(8) { const unsigned* cnt = (const unsigned*)(ws + WS_CTL) + CW_CNT + l * 4096; MoeTab M(lds); moe_tables(M, cnt, tid, lane, wave);
            UpOrder S{M, 0}; S.n = up_order_build(M, (const int*)(ws + WS_LIST), (const float*)(ws + WS_WL), wg, G, tid);
            constexpr int KU = MOE_UP_FP8 ? D / 2 : D;
            pg8::Gemm g{(const bf16*)(ws + WS_X1B), (const bf16*)(ws + WS_WUP), T, NEX * 1024, KU, KU, KU};
            EpiGluSparse E{(LAS const float*)M.wt, (bf16*)(ws + WS_HB)};
            auto S2 = MAKE_ORDER(8, S); pg8::gemm_phase_gather<EpiGluSparse, ORDER_T(8, UpOrder), MOE_UP_FP8 != 0>(lds, g, S2, E); } SEAM(8); }
        if (RUN(9)) { REP(9) { const unsigned* cnt = (const unsigned*)(ws + WS_CTL) + CW_CNT + l * 4096; MoeTab M(lds); moe_tables(M, cnt, tid, lane, wave);
            DownOrder S{M, G, wg, 8 * M.t[65]};
            constexpr int KD = MOE_DN_FP8 ? ED / 2 : ED;
            pg8::Gemm g{(const bf16*)(ws + WS_HB), (const bf16*)(ws + WS_WDN), HROWS, NEX * D, KD, KD, KD};
            EpiYexp E{(bf16*)(ws + WS_YEXP)};
            auto S2 = MAKE_ORDER(9, S); pg8::gemm_phase<EpiYexp, ORDER_T(9, DownOrder), true, true, MOE_DN_FP8 != 0>(lds, g, S2, E); } SEAM(9); }
        if (RUN(10)) { REP(10) { phase_combine_ln2(p, l, xout, l != NL - 1, gw, NGW, lane); } SEAM(10); }
#undef RUN
#undef SEAM
    }
}
__global__ void __launch_bounds__(512, 2) fwd_kernel(Params p) {
    extern __shared__ __attribute__((aligned(16))) unsigned char lds_raw[];
    LAS unsigned char* lds = (LAS unsigned char*)lds_raw;
    const int tid = threadIdx.x, lane = tid & 63, wave = __builtin_amdgcn_readfirstlane(tid >> 6);
    const int G = gridDim.x, wg = blockIdx.x, gw = wg * 8 + wave, NGW = G * 8;
    volatile LAS unsigned* MISC = (volatile LAS unsigned*)(lds + MISC_OFF);
    if (tid < 32) MISC[tid] = 0u;
    __syncthreads();
    unsigned* ctl = (unsigned*)(p.ws + WS_CTL);
    const bool multi = (p.ph_hi - p.ph_lo) > 1;
    XcdBarrier bar; bar.bar = ctl + CW_BAR; bar.x = 0; bar.st = nullptr;
    if (multi) bar = xcd_barrier_post(ctl + CW_BAR, MISC + 8);
    run_layer<0>(p, lds, bar, tid, lane, wave, G, wg, gw, NGW);
    run_layer<1>(p, lds, bar, tid, lane, wave, G, wg, gw, NGW);
}

#ifndef MK_MULTI_LAUNCH
#define MK_MULTI_LAUNCH 0
#endif
extern "C" void kernel_launch(void* const* d_in, const int* in_sizes, int n_in, void* d_out, int out_size, void* d_ws, size_t ws_size, hipStream_t stream) {
    static int grid = 0;
    if (grid == 0) {
        if (n_in != 27 || out_size != T * D || ws_size < WS_END) { fprintf(stderr, "kernel_launch: unexpected shapes (n_in %d out %d ws %zu need %zu)\n", n_in, out_size, ws_size, (size_t)WS_END); grid = -1; return; }
        int dev = 0, cus = 0, per_cu = 0;
        if (hipGetDevice(&dev) != hipSuccess || hipDeviceGetAttribute(&cus, hipDeviceAttributeMultiprocessorCount, dev) != hipSuccess) { grid = -1; return; }
        if (hipFuncSetAttribute((const void*)fwd_kernel, hipFuncAttributeMaxDynamicSharedMemorySize, LDS_BYTES) != hipSuccess) { fprintf(stderr, "kernel_launch: hipFuncSetAttribute failed\n"); grid = -1; return; }
        if (hipOccupancyMaxActiveBlocksPerMultiprocessor(&per_cu, (const void*)fwd_kernel, 512, LDS_BYTES) != hipSuccess || per_cu < 1) { fprintf(stderr, "kernel_launch: occupancy query says %d\n", per_cu); }
        (void)hipGetLastError();
        grid = cus;
    }
    if (grid < 0) return;
    (void)hipMemsetAsync((char*)d_ws + WS_CTL, 0, CTL_ZERO_BYTES, stream);
    Params p{};
    for (int i = 0; i < 27; ++i) p.in[i] = (const float*)d_in[i];
    p.out = (float*)d_out; p.ws = (unsigned char*)d_ws;
#if MK_MULTI_LAUNCH
    for (int ph = 0; ph < NL * NPH; ++ph) { p.ph_lo = ph; p.ph_hi = ph + 1; hipLaunchKernelGGL(fwd_kernel, dim3(grid), dim3(512), LDS_BYTES, stream, p); }
#else
    p.ph_lo = 0; p.ph_hi = NL * NPH; hipLaunchKernelGGL(fwd_kernel, dim3(grid), dim3(512), LDS_BYTES, stream, p);
#endif
}
```

```cpp
#include <hip/hip_runtime.h>
#include <cstdio>
#include <cstdint>
#include <type_traits>
namespace pg8 {
#define PG8_LAS __attribute__((address_space(3)))
typedef unsigned short bf16_t;
typedef short bf16x8 __attribute__((ext_vector_type(8)));
typedef float f32x4 __attribute__((ext_vector_type(4)));
typedef unsigned u32x4 __attribute__((ext_vector_type(4)));
constexpr int BM = 256, BK = 64, HALF = 128, HTB = HALF * BK * 2  , STAGE_BYTES = 8 * HTB, NXCD = 8, WGM = 8;

__host__ __device__ __forceinline__ int lds_byte(int r, int c) { const int st = (r >> 4) * 2 + (c >> 5), rr = r & 15, cc = c & 31, ob = rr * 64 + cc * 2; return st * 1024 + (ob ^ (((ob >> 9) & 1) << 5)); }
__host__ __device__ __forceinline__ void stage_rc(int b, int& R, int& C) { const int st = b / 1024, sb = b % 1024, swz = sb ^ (((sb >> 9) & 1) << 5); R = (st >> 1) * 16 + swz / 64; C = (st & 1) * 32 + (swz % 64) / 2; }
__host__ __device__ __forceinline__ int perm32(int rho) { const int n = rho >> 4, i = rho & 15; return 8 * (i >> 2) + 4 * n + (i & 3); }

struct Unit { int pm, pn, aux; };
struct Gemm { const bf16_t* A; const bf16_t* Bt; int M, N, K, lda, ldb; };

struct StaticOrder {
    int nM, nN, nwg, G, c;
    __host__ __device__ void init(int M, int N, int G_, int c_) { nM = M / BM; nN = N / BM; nwg = nM * nN; G = G_; c = c_; }
    __host__ __device__ bool next(int i, Unit& u) const {
        const long L = (long)i * G + c; if (L >= nwg) return false;
        int wgid = (int)L; { const int q = nwg / NXCD, r = nwg % NXCD, xcd = wgid % NXCD, off = wgid / NXCD; wgid = (xcd < r ? xcd * (q + 1) : r * (q + 1) + (xcd - r) * q) + off; }
        const int nig = WGM * nN, gid = wgid / nig, fm = gid * WGM, gsz = (nM - fm) < WGM ? (nM - fm) : WGM;
        u.pm = fm + ((wgid % nig) % gsz); u.pn = (wgid % nig) / gsz; return true;
    }
    __device__ __forceinline__ void a_ready(const Unit&) const {}
    __device__ __forceinline__ void done(const Unit&) const {}
};

__device__ __forceinline__ unsigned cvt_pk_bf16(float lo, float hi) { unsigned r; asm volatile("v_cvt_pk_bf16_f32 %0, %1, %2" : "=v"(r) : "v"(lo), "v"(hi)); return r; }
typedef float f32x2 __attribute__((ext_vector_type(2)));
__device__ __forceinline__ f32x2 gelu_pk(f32x2 v) {
    const f32x2 av = __builtin_elementwise_abs(v), d = av * 0.2316418882f + 1.0f;
    f32x2 t; t.x = __builtin_amdgcn_rcpf(d.x); t.y = __builtin_amdgcn_rcpf(d.y);
    f32x2 q = t * 0.5307027145f + (-0.7265760135f); q = q * t + 0.7107068705f; q = q * t + (-0.142248368f); q = q * t + 0.127414796f; q = q * t;
    const f32x2 s = (v * v) * (-0.72134752044f);
    f32x2 e; e.x = __builtin_amdgcn_exp2f(s.x); e.y = __builtin_amdgcn_exp2f(s.y);
    const f32x2 m = v * (q * e), r = v - m;
    f32x2 o; o.x = v.x < 0.f ? m.x : r.x; o.y = v.y < 0.f ? m.y : r.y; return o;
}

template <int ACT  > struct EpiBf16 {
    static constexpr bool PERM = true, AFTER_DRAIN = false; static constexpr int MID = 0; static_assert(ACT == 0 || ACT == 1, "EpiBf16: ACT is 0 (none) or 1 (gelu_pk)");
    bf16_t* O; int ldc; const float* bias; int split_cols; size_t split_stride; float scale0;
    __device__ __forceinline__ void operator()(const f32x4 (&acc)[2][2][4][2], const Unit& u, int wr, int wc, int fr, int fq) const {
        const int row0 = u.pm * BM + wr * 64 + fr; int colt = u.pn * BM; bf16_t* base = O;
        float sc = scale0; if (split_cols) { const int t = colt / split_cols; base += (size_t)t * split_stride; colt -= t * split_cols; if (t != 0) sc = 1.f; }
        const int col0 = colt + wc * 32 + 8 * fq, bcol0 = u.pn * BM + wc * 32 + 8 * fq;
        f32x4 bv[2][2];
#pragma unroll
        for (int bj = 0; bj < 2; ++bj)
#pragma unroll
            for (int n = 0; n < 2; ++n) bv[bj][n] = bias ? *(const f32x4*)(bias + bcol0 + bj * HALF + 4 * n) : (f32x4){0.f, 0.f, 0.f, 0.f};
#pragma unroll
        for (int ai = 0; ai < 2; ++ai)
#pragma unroll
            for (int m = 0; m < 4; ++m) { bf16_t* rowp = base + (size_t)(row0 + ai * HALF + m * 16) * ldc + col0;
#pragma unroll
                for (int bj = 0; bj < 2; ++bj) { f32x4 v0 = acc[ai][bj][m][0] + bv[bj][0], v1 = acc[ai][bj][m][1] + bv[bj][1];
                    if (ACT == 1) { f32x2 a = gelu_pk((f32x2){v0[0], v0[1]}), b = gelu_pk((f32x2){v0[2], v0[3]}), c = gelu_pk((f32x2){v1[0], v1[1]}), d = gelu_pk((f32x2){v1[2], v1[3]});
                        v0 = (f32x4){a.x, a.y, b.x, b.y}; v1 = (f32x4){c.x, c.y, d.x, d.y}; }
                    v0 = v0 * sc; v1 = v1 * sc; u32x4 w; w.x = cvt_pk_bf16(v0[0], v0[1]); w.y = cvt_pk_bf16(v0[2], v0[3]); w.z = cvt_pk_bf16(v1[0], v1[1]); w.w = cvt_pk_bf16(v1[2], v1[3]);
                    *(u32x4*)(rowp + bj * HALF) = w; } }
    }
};

typedef int i32x8 __attribute__((ext_vector_type(8)));
__device__ __forceinline__ i32x8 cat8(const bf16x8 a, const bf16x8 b) { typedef int i32x4 __attribute__((ext_vector_type(4))); const i32x4 x = __builtin_bit_cast(i32x4, a), y = __builtin_bit_cast(i32x4, b); return (i32x8){x[0], x[1], x[2], x[3], y[0], y[1], y[2], y[3]}; }
__device__ __forceinline__ bf16x8 lo8(const i32x8 v) { typedef int i32x4 __attribute__((ext_vector_type(4))); return __builtin_bit_cast(bf16x8, __builtin_shufflevector(v, v, 0, 1, 2, 3)); }
__device__ __forceinline__ bf16x8 hi8(const i32x8 v) { typedef int i32x4 __attribute__((ext_vector_type(4))); return __builtin_bit_cast(bf16x8, __builtin_shufflevector(v, v, 4, 5, 6, 7)); }
template <class Epi, class Sched, bool ALIGN_EPI = false, bool SP2 = false, bool FP8 = false>
__device__ __forceinline__ void gemm_phase(PG8_LAS unsigned char* lds, const Gemm g, const Sched& S, const Epi& E) {
    const int tid = threadIdx.x, wid = __builtin_amdgcn_readfirstlane(tid >> 6), lane = tid & 63, wr = wid >> 2, wc = wid & 3, fr = lane & 15, fq = lane >> 4;
    const int K = g.K, nt = K / BK;
    unsigned voffA[2], voffB[2];
#pragma unroll
    for (int i = 0; i < 2; ++i) { int R, C; stage_rc(tid * 16 + i * 8192, R, C); const int Rb = Epi::PERM ? ((R & ~31) + perm32(R & 31)) : R;
        voffA[i] = (unsigned)(R * g.lda + C) * 2u; voffB[i] = (unsigned)(Rb * g.ldb + C) * 2u; }
    const size_t kstep = (size_t)(BK * 2);
    const size_t hstepA = (size_t)HALF * g.lda * 2, hstepB = (size_t)HALF * g.ldb * 2;
    const size_t tstepA = 2 * hstepA, tstepB = 2 * hstepB;
    const unsigned ldsw = (unsigned)wid * 1024u;
    const int aoff = lds_byte(wr * 64 + fr, fq * 8), boff = lds_byte(wc * 32 + fr, fq * 8);
#define PG8_SA(b, h) (((b) * 2 + (h)) * HTB)
#define PG8_SB(b, h) ((4 + (b) * 2 + (h)) * HTB)
#define PG8_STAGE(bufoff, gbase, voff) do { _Pragma("unroll") for (int _i = 0; _i < 2; ++_i) \
        __builtin_amdgcn_global_load_lds((const unsigned*)((const char*)(gbase) + (voff)[_i]), (PG8_LAS unsigned*)(lds + (bufoff) + ldsw + _i * 8192), 16, 0, 0); } while (0)
#define PG8_LDA(dst, b, h) do { _Pragma("unroll") for (int m = 0; m < 4; ++m) { if constexpr (FP8) dst##8[m] = cat8(*(const PG8_LAS bf16x8*)(lds + PG8_SA(b, h) + aoff + m * 2048), *(const PG8_LAS bf16x8*)(lds + PG8_SA(b, h) + aoff + m * 2048 + 1024)); \
        else { _Pragma("unroll") for (int k = 0; k < 2; ++k) dst[m][k] = *(const PG8_LAS bf16x8*)(lds + PG8_SA(b, h) + aoff + m * 2048 + k * 1024); } } } while (0)
#define PG8_LDB(dst, b, h) do { _Pragma("unroll") for (int n = 0; n < 2; ++n) { if constexpr (FP8) dst##8[n] = cat8(*(const PG8_LAS bf16x8*)(lds + PG8_SB(b, h) + boff + n * 2048), *(const PG8_LAS bf16x8*)(lds + PG8_SB(b, h) + boff + n * 2048 + 1024)); \
        else { _Pragma("unroll") for (int k = 0; k < 2; ++k) dst[n][k] = *(const PG8_LAS bf16x8*)(lds + PG8_SB(b, h) + boff + n * 2048 + k * 1024); } } } while (0)
#define PG8_MMA(ai, bj, At, Bt) do { __builtin_amdgcn_s_setprio(1); _Pragma("unroll") for (int m = 0; m < 4; ++m) _Pragma("unroll") for (int n = 0; n < 2; ++n) { \
        if constexpr (FP8) asm volatile("v_mfma_scale_f32_16x16x128_f8f6f4 %0, %1, %2, %0, %3, %3 op_sel_hi:[0,0,0]" : "+v"(acc[ai][bj][m][n]) : "v"(Bt##8[n]), "v"(At##8[m]), "v"(fp8_unit_scale)); \
        else { _Pragma("unroll") for (int k = 0; k < 2; ++k) acc[ai][bj][m][n] = __builtin_amdgcn_mfma_f32_16x16x32_bf16(Bt[n][k], At[m][k], acc[ai][bj][m][n], 0, 0, 0); } } __builtin_amdgcn_s_setprio(0); } while (0)
#define PG8_WAIT_V(n) asm volatile("s_waitcnt vmcnt(" #n ")" ::: "memory")
#define PG8_WAIT_L(n) asm volatile("s_waitcnt lgkmcnt(" #n ")" ::: "memory")
#define PG8_BAR __builtin_amdgcn_s_barrier()
#define PG8_SCHED __builtin_amdgcn_sched_barrier(0)
    Unit cur, nxt; int ui = 0;
    if (!S.next(0, cur)) return;
    f32x4 acc[2][2][4][2];
#pragma unroll
    for (int a = 0; a < 2; ++a)
#pragma unroll
        for (int b = 0; b < 2; ++b)
#pragma unroll
            for (int m = 0; m < 4; ++m)
#pragma unroll
                for (int n = 0; n < 2; ++n) acc[a][b][m][n] = (f32x4){0.f, 0.f, 0.f, 0.f};
    int fp8_unit_scale = 0x7F7F7F7F; asm volatile("" : "+v"(fp8_unit_scale));
    bf16x8 At[4][2], B0[2][2], B1[2][2];
    i32x8 At8[4], B08[2], B18[2];
    const char* cA = (const char*)g.A + (size_t)cur.pm * tstepA; const char* cB = (const char*)g.Bt + (size_t)cur.pn * tstepB;
    S.a_ready(cur);
    if constexpr (SP2) {
        PG8_STAGE(PG8_SB(0, 0), cB, voffB); PG8_STAGE(PG8_SB(0, 1), cB + hstepB, voffB); PG8_STAGE(PG8_SA(0, 0), cA, voffA); PG8_STAGE(PG8_SA(0, 1), cA + hstepA, voffA);
        if (wr == 1) PG8_BAR;
        PG8_WAIT_V(2); PG8_BAR;
        PG8_STAGE(PG8_SB(1, 0), cB + kstep, voffB); PG8_STAGE(PG8_SA(1, 0), cA + kstep, voffA); PG8_STAGE(PG8_SB(1, 1), cB + hstepB + kstep, voffB);
        PG8_WAIT_V(6); PG8_BAR;
    } else {
        PG8_STAGE(PG8_SB(0, 0), cB, voffB); PG8_STAGE(PG8_SA(0, 0), cA, voffA); PG8_STAGE(PG8_SB(0, 1), cB + hstepB, voffB); PG8_STAGE(PG8_SA(0, 1), cA + hstepA, voffA);
        if (wr == 1) PG8_BAR;
        PG8_WAIT_V(4); PG8_BAR;
        PG8_STAGE(PG8_SB(1, 0), cB + kstep, voffB); PG8_STAGE(PG8_SA(1, 0), cA + kstep, voffA); PG8_STAGE(PG8_SB(1, 1), cB + hstepB + kstep, voffB);
        PG8_WAIT_V(6); PG8_BAR;
    }
    for (;;) {
        const bool has_next = S.next(ui + 1, nxt);
        const char* nA = has_next ? (const char*)g.A + (size_t)nxt.pm * tstepA : cA; const char* nB = has_next ? (const char*)g.Bt + (size_t)nxt.pn * tstepB : cB;
        for (int t = 0; t < nt; t += 2) {
            const bool last = (t == nt - 2);
            const char* a1 = cA + (size_t)(t + 1) * kstep;
            const char* a2 = last ? nA : cA + (size_t)(t + 2) * kstep; const char* b2 = last ? nB : cB + (size_t)(t + 2) * kstep;
            const char* a3 = a2 + kstep; const char* b3 = b2 + kstep;
            if (last && has_next) S.a_ready(nxt);
            if constexpr (SP2) {
            if constexpr (Epi::MID > 0) { if (t != 0 && (t % Epi::MID) == 0) { PG8_SCHED; if constexpr (FP8) asm volatile("s_nop 7\n\ts_nop 7" ::: "memory"); E.mid(acc, cur, t / Epi::MID, wr, wc, fr, fq); if constexpr (FP8) asm volatile("s_nop 7" ::: "memory"); PG8_SCHED; } }
            PG8_LDB(B0, 0, 0); PG8_LDB(B1, 0, 1); PG8_SCHED; PG8_LDA(At, 0, 0); PG8_STAGE(PG8_SA(1, 1), a1 + hstepA, voffA);
            PG8_WAIT_V(8); PG8_WAIT_L(0); PG8_BAR; PG8_MMA(0, 0, At, B0); PG8_MMA(0, 1, At, B1); PG8_BAR; PG8_SCHED;
            PG8_LDA(At, 0, 1); PG8_STAGE(PG8_SB(0, 0), b2, voffB); PG8_STAGE(PG8_SB(0, 1), b2 + hstepB, voffB); PG8_STAGE(PG8_SA(0, 0), a2, voffA);
            PG8_WAIT_V(8); PG8_WAIT_L(0); PG8_BAR; PG8_MMA(1, 0, At, B0); PG8_MMA(1, 1, At, B1); PG8_BAR; PG8_SCHED;
            PG8_LDB(B0, 1, 0); PG8_LDB(B1, 1, 1); PG8_SCHED; PG8_LDA(At, 1, 0); PG8_STAGE(PG8_SA(0, 1), a2 + hstepA, voffA);
            PG8_WAIT_V(8); PG8_WAIT_L(0); PG8_BAR; PG8_MMA(0, 0, At, B0); PG8_MMA(0, 1, At, B1); PG8_BAR; PG8_SCHED;
            PG8_LDA(At, 1, 1); PG8_STAGE(PG8_SB(1, 0), b3, voffB); PG8_STAGE(PG8_SB(1, 1), b3 + hstepB, voffB); PG8_STAGE(PG8_SA(1, 0), a3, voffA);
            PG8_WAIT_V(8); PG8_WAIT_L(0); PG8_BAR; PG8_MMA(1, 0, At, B0); PG8_MMA(1, 1, At, B1); PG8_BAR; PG8_SCHED;
            } else {
            PG8_LDB(B0, 0, 0); PG8_SCHED; PG8_LDA(At, 0, 0); PG8_STAGE(PG8_SA(1, 1), a1 + hstepA, voffA);
            PG8_WAIT_L(8); PG8_BAR; PG8_WAIT_L(0); PG8_MMA(0, 0, At, B0); PG8_BAR; PG8_SCHED;
            PG8_LDB(B1, 0, 1); PG8_STAGE(PG8_SB(0, 0), b2, voffB);
            PG8_BAR; PG8_WAIT_L(0); PG8_MMA(0, 1, At, B1); PG8_BAR;
            PG8_LDA(At, 0, 1); PG8_STAGE(PG8_SA(0, 0), a2, voffA);
            PG8_BAR; PG8_WAIT_L(0); PG8_MMA(1, 0, At, B0); PG8_BAR; PG8_SCHED;
            PG8_STAGE(PG8_SB(0, 1), b2 + hstepB, voffB);
            PG8_WAIT_V(6); PG8_BAR; PG8_MMA(1, 1, At, B1); PG8_BAR;
            PG8_LDB(B0, 1, 0); PG8_SCHED; PG8_LDA(At, 1, 0); PG8_STAGE(PG8_SA(0, 1), a2 + hstepA, voffA);
            PG8_WAIT_L(8); PG8_BAR; PG8_WAIT_L(0); PG8_MMA(0, 0, At, B0); PG8_BAR; PG8_SCHED;
            PG8_LDB(B1, 1, 1); PG8_STAGE(PG8_SB(1, 0), b3, voffB);
            PG8_BAR; PG8_WAIT_L(0); PG8_MMA(0, 1, At, B1); PG8_BAR;
            PG8_LDA(At, 1, 1); PG8_STAGE(PG8_SA(1, 0), a3, voffA);
            PG8_BAR; PG8_WAIT_L(0); PG8_MMA(1, 0, At, B0); PG8_BAR; PG8_SCHED;
            PG8_STAGE(PG8_SB(1, 1), b3 + hstepB, voffB);
            PG8_WAIT_V(6); PG8_BAR; PG8_MMA(1, 1, At, B1); PG8_BAR;
            }
        }
        if constexpr (ALIGN_EPI) { if (wr == 0) PG8_BAR; }
        if constexpr (FP8) asm volatile("s_nop 7\n\ts_nop 7" ::: "memory");
        if constexpr (!Epi::AFTER_DRAIN) { E(acc, cur, wr, wc, fr, fq); S.done(cur); }
        if (!has_next) break;
#pragma unroll
        for (int a = 0; a < 2; ++a)
#pragma unroll
            for (int b = 0; b < 2; ++b)
#pragma unroll
                for (int m = 0; m < 4; ++m)
#pragma unroll
                    for (int n = 0; n < 2; ++n) acc[a][b][m][n] = (f32x4){0.f, 0.f, 0.f, 0.f};
        cur = nxt; cA = nA; cB = nB; ++ui;
        if constexpr (ALIGN_EPI) { if (wr == 1) PG8_BAR; }
    }
    PG8_WAIT_V(0);
    if constexpr (!ALIGN_EPI) { if (wr == 0) PG8_BAR; }
    PG8_BAR;
    if constexpr (Epi::AFTER_DRAIN) { E.fused(acc, cur, wr, wc, fr, fq, lds, wid, lane); S.done(cur); }
#undef PG8_SA
#undef PG8_SB
#undef PG8_STAGE
#undef PG8_LDA
#undef PG8_LDB
#undef PG8_MMA
#undef PG8_WAIT_V
#undef PG8_WAIT_L
#undef PG8_BAR
#undef PG8_SCHED
}
template <class Epi, class Sched, bool FP8 = false>
__device__ __forceinline__ void gemm_phase_gather(PG8_LAS unsigned char* lds, const Gemm g, const Sched& S, const Epi& E) {
    const int tid = threadIdx.x, wid = __builtin_amdgcn_readfirstlane(tid >> 6), lane = tid & 63, wr = wid >> 2, wc = wid & 3, fr = lane & 15, fq = lane >> 4;
    const int K = g.K, nt = K / BK;
    unsigned voffB[2]; int RA[2], CA[2];
#pragma unroll
    for (int i = 0; i < 2; ++i) { int R, C; stage_rc(tid * 16 + i * 8192, R, C); const int Rb = Epi::PERM ? ((R & ~31) + perm32(R & 31)) : R;
        RA[i] = R; CA[i] = C; voffB[i] = (unsigned)(Rb * g.ldb + C) * 2u; }
    const size_t kstep = (size_t)(BK * 2);
    const size_t hstepB = (size_t)HALF * g.ldb * 2, tstepB = 2 * hstepB;
    const unsigned ldsw = (unsigned)wid * 1024u;
    const int aoff = lds_byte(wr * 64 + fr, fq * 8), boff = lds_byte(wc * 32 + fr, fq * 8);
#define PG8_SA(b, h) (((b) * 2 + (h)) * HTB)
#define PG8_SB(b, h) ((4 + (b) * 2 + (h)) * HTB)
#define PG8_STAGE(bufoff, gbase, voff) do { _Pragma("unroll") for (int _i = 0; _i < 2; ++_i) \
        __builtin_amdgcn_global_load_lds((const unsigned*)((const char*)(gbase) + (voff)[_i]), (PG8_LAS unsigned*)(lds + (bufoff) + ldsw + _i * 8192), 16, 0, 0); } while (0)
#define PG8_LDA(dst, b, h) do { _Pragma("unroll") for (int m = 0; m < 4; ++m) { if constexpr (FP8) dst##8[m] = cat8(*(const PG8_LAS bf16x8*)(lds + PG8_SA(b, h) + aoff + m * 2048), *(const PG8_LAS bf16x8*)(lds + PG8_SA(b, h) + aoff + m * 2048 + 1024)); \
        else { _Pragma("unroll") for (int k = 0; k < 2; ++k) dst[m][k] = *(const PG8_LAS bf16x8*)(lds + PG8_SA(b, h) + aoff + m * 2048 + k * 1024); } } } while (0)
#define PG8_LDB(dst, b, h) do { _Pragma("unroll") for (int n = 0; n < 2; ++n) { if constexpr (FP8) dst##8[n] = cat8(*(const PG8_LAS bf16x8*)(lds + PG8_SB(b, h) + boff + n * 2048), *(const PG8_LAS bf16x8*)(lds + PG8_SB(b, h) + boff + n * 2048 + 1024)); \
        else { _Pragma("unroll") for (int k = 0; k < 2; ++k) dst[n][k] = *(const PG8_LAS bf16x8*)(lds + PG8_SB(b, h) + boff + n * 2048 + k * 1024); } } } while (0)
#define PG8_MMA(ai, bj, At, Bt) do { __builtin_amdgcn_s_setprio(1); _Pragma("unroll") for (int m = 0; m < 4; ++m) _Pragma("unroll") for (int n = 0; n < 2; ++n) { \
        if constexpr (FP8) asm volatile("v_mfma_scale_f32_16x16x128_f8f6f4 %0, %1, %2, %0, %3, %3 op_sel_hi:[0,0,0]" : "+v"(acc[ai][bj][m][n]) : "v"(Bt##8[n]), "v"(At##8[m]), "v"(fp8_unit_scale)); \
        else { _Pragma("unroll") for (int k = 0; k < 2; ++k) acc[ai][bj][m][n] = __builtin_amdgcn_mfma_f32_16x16x32_bf16(Bt[n][k], At[m][k], acc[ai][bj][m][n], 0, 0, 0); } } __builtin_amdgcn_s_setprio(0); } while (0)
#define PG8_WAIT_V(n) asm volatile("s_waitcnt vmcnt(" #n ")" ::: "memory")
#define PG8_WAIT_L(n) asm volatile("s_waitcnt lgkmcnt(" #n ")" ::: "memory")
#define PG8_BAR __builtin_amdgcn_s_barrier()
#define PG8_SCHED __builtin_amdgcn_sched_barrier(0)
#define PG8_ROWS(dst, ui_) do { _Pragma("unroll") for (int _h = 0; _h < 2; ++_h) _Pragma("unroll") for (int _i = 0; _i < 2; ++_i) \
        dst[_h][_i] = (unsigned)S.row_token((ui_), _h * HALF + RA[_i]) * (unsigned)(g.lda * 2) + (unsigned)(CA[_i] * 2); } while (0)
    Unit cur, nxt; int ui = 0;
    if (!S.next(0, cur)) return;
    f32x4 acc[2][2][4][2];
#pragma unroll
    for (int a = 0; a < 2; ++a)
#pragma unroll
        for (int b = 0; b < 2; ++b)
#pragma unroll
            for (int m = 0; m < 4; ++m)
#pragma unroll
                for (int n = 0; n < 2; ++n) acc[a][b][m][n] = (f32x4){0.f, 0.f, 0.f, 0.f};
    int fp8_unit_scale = 0x7F7F7F7F; asm volatile("" : "+v"(fp8_unit_scale));
    bf16x8 At[4][2], B0[2][2], B1[2][2];
    i32x8 At8[4], B08[2], B18[2];
    unsigned offC[2][2];
    PG8_ROWS(offC, 0);
    const char* gA = (const char*)g.A;
    const char* cB = (const char*)g.Bt + (size_t)cur.pn * tstepB;
    PG8_STAGE(PG8_SB(0, 0), cB, voffB); PG8_STAGE(PG8_SB(0, 1), cB + hstepB, voffB); PG8_STAGE(PG8_SA(0, 0), gA, offC[0]); PG8_STAGE(PG8_SA(0, 1), gA, offC[1]);
    if (wr == 1) PG8_BAR;
    PG8_WAIT_V(2); PG8_BAR;
    PG8_STAGE(PG8_SB(1, 0), cB + kstep, voffB); PG8_STAGE(PG8_SA(1, 0), gA + kstep, offC[0]); PG8_STAGE(PG8_SB(1, 1), cB + hstepB + kstep, voffB);
    PG8_WAIT_V(6); PG8_BAR;
    for (;;) {
        const bool has_next = S.next(ui + 1, nxt);
        const char* nB = has_next ? (const char*)g.Bt + (size_t)nxt.pn * tstepB : cB;
        for (int t = 0; t < nt; t += 2) {
            const bool last = (t == nt - 2);
            const char* a1 = gA + (size_t)(t + 1) * kstep;
            const char* a2 = last ? gA : gA + (size_t)(t + 2) * kstep; const char* b2 = last ? nB : cB + (size_t)(t + 2) * kstep;
            const char* a3 = a2 + kstep; const char* b3 = b2 + kstep;
            PG8_LDB(B0, 0, 0); PG8_LDB(B1, 0, 1); PG8_SCHED; PG8_LDA(At, 0, 0); PG8_STAGE(PG8_SA(1, 1), a1, offC[1]);
            if (last && has_next) { PG8_ROWS(offC, ui + 1); }
            PG8_WAIT_V(8); PG8_WAIT_L(0); PG8_BAR; PG8_MMA(0, 0, At, B0); PG8_MMA(0, 1, At, B1); PG8_BAR; PG8_SCHED;
            PG8_LDA(At, 0, 1); PG8_STAGE(PG8_SB(0, 0), b2, voffB); PG8_STAGE(PG8_SB(0, 1), b2 + hstepB, voffB); PG8_STAGE(PG8_SA(0, 0), a2, offC[0]);
            PG8_WAIT_V(8); PG8_WAIT_L(0); PG8_BAR; PG8_MMA(1, 0, At, B0); PG8_MMA(1, 1, At, B1); PG8_BAR; PG8_SCHED;
            PG8_LDB(B0, 1, 0); PG8_LDB(B1, 1, 1); PG8_SCHED; PG8_LDA(At, 1, 0); PG8_STAGE(PG8_SA(0, 1), a2, offC[1]);
            PG8_WAIT_V(8); PG8_WAIT_L(0); PG8_BAR; PG8_MMA(0, 0, At, B0); PG8_MMA(0, 1, At, B1); PG8_BAR; PG8_SCHED;
            PG8_LDA(At, 1, 1); PG8_STAGE(PG8_SB(1, 0), b3, voffB); PG8_STAGE(PG8_SB(1, 1), b3 + hstepB, voffB); PG8_STAGE(PG8_SA(1, 0), a3, offC[0]);
            PG8_WAIT_V(8); PG8_WAIT_L(0); PG8_BAR; PG8_MMA(1, 0, At, B0); PG8_MMA(1, 1, At, B1); PG8_BAR; PG8_SCHED;
        }
        if (wr == 0) PG8_BAR;
        if constexpr (FP8) asm volatile("s_nop 7\n\ts_nop 7" ::: "memory");
        E(acc, cur, wr, wc, fr, fq); S.done(cur);
        if (!has_next) break;
#pragma unroll
        for (int a = 0; a < 2; ++a)
#pragma unroll
            for (int b = 0; b < 2; ++b)
#pragma unroll
                for (int m = 0; m < 4; ++m)
#pragma unroll
                    for (int n = 0; n < 2; ++n) acc[a][b][m][n] = (f32x4){0.f, 0.f, 0.f, 0.f};
        cur = nxt; cB = nB; ++ui;
        if (wr == 1) PG8_BAR;
    }
    PG8_WAIT_V(0);
    PG8_BAR;
#undef PG8_ROWS
#undef PG8_SA
#undef PG8_SB
#undef PG8_STAGE
#undef PG8_LDA
#undef PG8_LDB
#undef PG8_MMA
#undef PG8_WAIT_V
#undef PG8_WAIT_L
#undef PG8_BAR
#undef PG8_SCHED
}
}

#ifndef MERGE_FP8
#define MERGE_FP8 1
#endif
#ifndef MOE_DN_FP8
#define MOE_DN_FP8 1
#endif
#ifndef MOE_UP_FP8
#define MOE_UP_FP8 1
#endif
#ifndef PROBE_NOATOM
#define PROBE_NOATOM 0
#endif
constexpr int T = 8192, D = 2048, NL = 2, BW = 512, ZC = 14336, INC = 14352;
constexpr int NE = 64, NEX = 65  , ED = 512;
constexpr int BRW = 4 * BW;
constexpr int HK = NEX * ED;
constexpr float ALPHA = 1.41421356237f;
constexpr float LN_EPS = 1e-5f;
constexpr float UPSC = MOE_UP_FP8 ? (1.f / 64.f) : 1.f;
constexpr float BRSC = MERGE_FP8 ? 8.f : 1.f, MGSC = MERGE_FP8 ? (1.f / (8.f * 64.f)) : 1.f;
constexpr float HSC = 8.f, DNSC = MOE_DN_FP8 ? (1.f / (HSC * 64.f)) : 1.f;
constexpr int ZC_SBQ = 0, ZC_SBK = 512, ZC_SBV = 1024, ZC_GMU = 1536, ZC_GMV = 2048, ZC_GDN = 2560, ZC_GDNG = 4096,
              ZC_MLQ = 4608, ZC_MLK = 4864, ZC_MLV = 5120, ZC_MLO = 5632, ZC_GATE = 6144;

#define GAS __attribute__((address_space(1)))
#define LAS __attribute__((address_space(3)))
typedef unsigned short bf16;
typedef unsigned v4u __attribute__((ext_vector_type(4)));
typedef unsigned v2u __attribute__((ext_vector_type(2)));
typedef float v4f __attribute__((ext_vector_type(4)));
typedef float v2f __attribute__((ext_vector_type(2)));
#define LDS_WAIT() asm volatile("s_waitcnt lgkmcnt(0)" ::: "memory")
#define LDS_BAR() do { asm volatile("s_waitcnt lgkmcnt(0)" ::: "memory"); __builtin_amdgcn_s_barrier(); asm volatile("" ::: "memory"); } while (0)

constexpr size_t MiB = 1u << 20;
constexpr size_t WS_CTL = 0, CTL_ZERO_BYTES = 1 * MiB;
constexpr size_t WS_WIN = 2 * MiB, WS_WBR = 58 * MiB, WS_WOUT = 66 * MiB, WS_WUP = 74 * MiB, WS_WDN = 334 * MiB;
constexpr size_t WS_XB = 464 * MiB, WS_SMALL = 496 * MiB, WS_EG = 497 * MiB, WS_BETA = WS_EG + 256 * 1024, WS_COMB = 498 * MiB;
constexpr size_t WS_Z = 500 * MiB, WS_GQ = 724 * MiB, WS_GK = 740 * MiB, WS_GV = 756 * MiB, WS_GO = 772 * MiB, WS_HO = 788 * MiB;
constexpr size_t WS_BR = 804 * MiB, WS_MTMP = 836 * MiB, WS_MSUM = 900 * MiB, WS_Y = 932 * MiB, WS_X1 = 996 * MiB, WS_X1B = 1060 * MiB;
constexpr size_t WS_XCUR = 1092 * MiB, WS_HB = 1156 * MiB, WS_YEXP = 1236 * MiB, WS_LIST = 1524 * MiB, WS_WL = 1526 * MiB, WS_SLOT = 1528 * MiB, WS_MQ = 1530 * MiB, WS_MS = 1534 * MiB, WS_MK = 1538 * MiB, WS_MV = 1542 * MiB, WS_MFL = 1552 * MiB, WS_HDEN = WS_MFL + 65536, WS_VT = 1553 * MiB, WS_END = 1561 * MiB;
constexpr size_t WS_GU = WS_GQ, WS_GNW = WS_GK, WS_GQG = WS_GK + 8 * MiB, WS_GKT = WS_GV, WS_GAT = WS_GV + 8 * MiB, WS_GDL = WS_GV + 12 * MiB;
constexpr int HROWS = 73728;
static_assert(WS_HB + (size_t)HROWS * ED * 2 <= WS_YEXP && WS_YEXP + (size_t)HROWS * D * 2 <= WS_LIST, "ws map (moe)");
static_assert(WS_WIN + (size_t)ZC * D * 2 <= WS_WBR && WS_WUP + (size_t)NEX * 1024 * D * 2 <= WS_WDN && WS_WDN + (size_t)D * HK * 2 <= WS_XB, "ws map (weights)");
static_assert(WS_Z + (size_t)T * ZC * 2 <= WS_GQ, "ws map (acts)");
constexpr int CW_BAR = 4096, CW_CNT = 16384;
constexpr int TAB_OFF = 131072 + 1024;
constexpr int LDS_BYTES = 163840, MISC_OFF = 131072 + 320;

__device__ __forceinline__ float bflo(unsigned w) { return __uint_as_float(w << 16); }
__device__ __forceinline__ float bfhi(unsigned w) { return __uint_as_float(w & 0xffff0000u); }
__device__ __forceinline__ unsigned f2bf(float f) { unsigned u = __float_as_uint(f); return (u + 0x7fffu + ((u >> 16) & 1u)) >> 16; }
__device__ __forceinline__ unsigned pk2(float lo, float hi) { return f2bf(lo) | (f2bf(hi) << 16); }
__device__ __forceinline__ unsigned pk4_f8(float a, float b, float c, float d, float sc) {
    a = __builtin_amdgcn_fmed3f(a * sc, -448.f, 448.f); b = __builtin_amdgcn_fmed3f(b * sc, -448.f, 448.f); c = __builtin_amdgcn_fmed3f(c * sc, -448.f, 448.f); d = __builtin_amdgcn_fmed3f(d * sc, -448.f, 448.f);
    unsigned w = 0; w = __builtin_amdgcn_cvt_pk_fp8_f32(a, b, w, false); w = __builtin_amdgcn_cvt_pk_fp8_f32(c, d, w, true); return w; }
__device__ __forceinline__ v4f ld4(const void* base, size_t idx, bool is_bf16) {
    if (is_bf16) { const v2u r = *(const v2u*)((const unsigned short*)base + idx); return (v4f){bflo(r.x), bfhi(r.x), bflo(r.y), bfhi(r.y)}; }
    return *(const v4f*)((const float*)base + idx); }
template <int CTRL> __device__ __forceinline__ float dpp(float x) { return __builtin_bit_cast(float, __builtin_amdgcn_mov_dpp(__builtin_bit_cast(int, x), CTRL, 0xf, 0xf, true)); }
__device__ __forceinline__ float sum4(float x) { x += dpp<0xB1>(x); x += dpp<0x4E>(x); return x; }
__device__ __forceinline__ float sum8(float x) { x = sum4(x); x += dpp<0x141>(x); return x; }
__device__ __forceinline__ float sum16(float x) { x = sum8(x); x += dpp<0x140>(x); return x; }
__device__ __forceinline__ float wave_sum(float x) { x = sum16(x); x += __shfl_xor(x, 16); x += __shfl_xor(x, 32); return x; }
__device__ __forceinline__ float max8(float x) { x = fmaxf(x, dpp<0xB1>(x)); x = fmaxf(x, dpp<0x4E>(x)); x = fmaxf(x, dpp<0x141>(x)); return x; }
__device__ __forceinline__ float min8(float x) { x = fminf(x, dpp<0xB1>(x)); x = fminf(x, dpp<0x4E>(x)); x = fminf(x, dpp<0x141>(x)); return x; }
__device__ __forceinline__ float wave_scan_incl(float v) {
    v += __builtin_bit_cast(float, __builtin_amdgcn_update_dpp(0, __builtin_bit_cast(int, v), 0x111, 0xf, 0xf, true));
    v += __builtin_bit_cast(float, __builtin_amdgcn_update_dpp(0, __builtin_bit_cast(int, v), 0x112, 0xf, 0xf, true));
    v += __builtin_bit_cast(float, __builtin_amdgcn_update_dpp(0, __builtin_bit_cast(int, v), 0x114, 0xf, 0xf, true));
    v += __builtin_bit_cast(float, __builtin_amdgcn_update_dpp(0, __builtin_bit_cast(int, v), 0x118, 0xf, 0xf, true));
    v += __builtin_bit_cast(float, __builtin_amdgcn_update_dpp(0, __builtin_bit_cast(int, v), 0x142, 0xa, 0xf, false));
    v += __builtin_bit_cast(float, __builtin_amdgcn_update_dpp(0, __builtin_bit_cast(int, v), 0x143, 0xc, 0xf, false));
    return v;
}
__device__ __forceinline__ float sigmoidf_(float x) { return 1.f / (1.f + __expf(-x)); }
__device__ __forceinline__ float siluf_(float x) { return x / (1.f + __expf(-x)); }
__device__ __forceinline__ float softplusf_(float x) { return fmaxf(x, 0.f) + __logf(1.f + __expf(-fabsf(x))); }
__device__ __forceinline__ float gelu_tanh(float x) { const float y = 0.7978845608f * (x + 0.044715f * x * x * x); const float t = 1.f - 2.f / (__expf(2.f * y) + 1.f); return 0.5f * x * (1.f + t); }
__device__ __forceinline__ void unpack8(const v4u r, float (&f)[8]) { f[0] = bflo(r.x); f[1] = bfhi(r.x); f[2] = bflo(r.y); f[3] = bfhi(r.y); f[4] = bflo(r.z); f[5] = bfhi(r.z); f[6] = bflo(r.w); f[7] = bfhi(r.w); }
#define XB_TMO      128
#define XB_XCNT(j)  (256  + 64 * (j))
#define XB_XSUB(j)  (1280 + 64 * (j))
#define XB_XGEN(j)  (2304 + 64 * (j))
#define XB_TOP      3328
#define XB_TOPGEN   3392
#define XCD_BAR_WORDS 3456
#define XB_SPIN_CAP (1u << 18)

__device__ __forceinline__ unsigned xb_ld(unsigned* p)              { return __hip_atomic_load(p, __ATOMIC_RELAXED, __HIP_MEMORY_SCOPE_AGENT); }
__device__ __forceinline__ unsigned xb_add(unsigned* p, unsigned v) { return __hip_atomic_fetch_add(p, v, __ATOMIC_RELAXED, __HIP_MEMORY_SCOPE_AGENT); }
__device__ __forceinline__ unsigned xb_xcc_id() { return (unsigned)__builtin_amdgcn_s_getreg((3 << 11) | 20) & 0xFu; }
#define XB_SPIN(cond, bar) do { unsigned _sp = 0; while (cond) { __builtin_amdgcn_s_sleep(1); \
    if ((++_sp & 255u) == 0u) { if (xb_ld(&(bar)[XB_TMO])) break; if (_sp > XB_SPIN_CAP) { atomicAdd(&(bar)[XB_TMO], 1u); break; } } } } while (0)

struct XcdBarrier {
    unsigned* bar; unsigned x;
    volatile LAS unsigned* st;
};

__device__ __forceinline__ XcdBarrier xcd_barrier_post(unsigned* bar, volatile LAS unsigned* st) {
    XcdBarrier b; b.bar = bar; b.x = xb_xcc_id(); b.st = st;
    if (threadIdx.x == 0) (void)xb_add(&bar[XB_XCNT(b.x)], 1u);
    return b;
}
__device__ __forceinline__ void xcd_barrier_complete(unsigned* bar, unsigned x, unsigned& nloc, unsigned& nx) {
    const unsigned G = gridDim.x * gridDim.y * gridDim.z;
    unsigned sum, cnt, mine, sp = 0u;
    for (;;) {
        sum = 0u; cnt = 0u; mine = 0u;
#pragma unroll
        for (unsigned j = 0; j < 16; ++j) { const unsigned c = xb_ld(&bar[XB_XCNT(j)]); sum += c; cnt += (c > 0u) ? 1u : 0u; mine = (j == x) ? c : mine; }
        if (sum == G) break;
        __builtin_amdgcn_s_sleep(1);
        if ((++sp & 255u) == 0u) { if (xb_ld(&bar[XB_TMO])) break; if (sp > XB_SPIN_CAP) { atomicAdd(&bar[XB_TMO], 1u); break; } }
    }
    nloc = mine > 0u ? mine : 1u; nx = cnt > 0u ? cnt : 1u;
}

__device__ __forceinline__ void xcd_barrier(const XcdBarrier& b) {
    asm volatile("s_waitcnt vmcnt(0)" ::: "memory");
    __syncthreads();
    if (threadIdx.x == 0) {
        unsigned* bar = b.bar;
        __builtin_amdgcn_s_waitcnt(0);
        unsigned nloc = b.st[0], nx = b.st[1];
        if (nloc == 0u) { xcd_barrier_complete(bar, b.x, nloc, nx); b.st[0] = nloc; b.st[1] = nx; }
        const unsigned old = xb_add(&bar[XB_XSUB(b.x)], 1u);
        const unsigned gen = old / nloc;
        if (old + 1u == (gen + 1u) * nloc) {
            __builtin_amdgcn_fence(__ATOMIC_RELEASE, "agent");
            asm volatile("s_waitcnt vmcnt(0)" ::: "memory");
            const unsigned og = xb_add(&bar[XB_TOP], 1u);
            const unsigned tg = og / nx;
            if (og + 1u == (tg + 1u) * nx) xb_add(&bar[XB_TOPGEN], 1u);
            else XB_SPIN(xb_ld(&bar[XB_TOPGEN]) == tg, bar);
            __builtin_amdgcn_fence(__ATOMIC_ACQUIRE, "agent");
            xb_add(&bar[XB_XGEN(b.x)], 1u);
            asm volatile("s_waitcnt vmcnt(0)" ::: "memory");
        } else {
            XB_SPIN(xb_ld(&bar[XB_XGEN(b.x)]) == gen, bar);
            __builtin_amdgcn_fence(__ATOMIC_ACQUIRE, "agent");
            asm volatile("s_waitcnt vmcnt(0)" ::: "memory");
        }
    }
    __syncthreads();
}

struct Params { const float* in[27]; float* out; unsigned char* ws; int ph_lo, ph_hi; };
enum { I_X = 0, I_WIN, I_GMNG, I_GMNB, I_GMWS, I_GMBS, I_CONVW, I_ALOG, I_DTB, I_GDNNG, I_MLIB, I_MLFB, I_MLNG, I_WBR, I_WOUT, I_LN1G, I_LN1B,
       I_WR, I_RB, I_WG, I_WU, I_WD, I_SG, I_SU, I_SD, I_LN2G, I_LN2B };

using pg8::f32x4; using pg8::u32x4; using pg8::Unit; using pg8::HALF; using pg8::BM;

struct EpiMergeH {
    static constexpr bool PERM = true, AFTER_DRAIN = false; static constexpr int MID = MERGE_FP8 ? BW / (2 * pg8::BK) : BW / pg8::BK;
    const bf16* Z; bf16* msum;
    __device__ __forceinline__ void mid(f32x4 (&acc)[2][2][4][2], const Unit& u, int j, int wr, int wc, int fr, int fq) const {
        int row0 = u.pm * BM + wr * 64 + fr; const int col0 = u.pn * BM + wc * 32 + 8 * fq; asm volatile("" : "+v"(row0));
        const bf16* zp = Z + ZC_GATE + (size_t)(j - 1) * D + col0;
#pragma unroll
        for (int am = 0; am < 4; ++am) { const int ai = am >> 1, m0 = (am & 1) * 2; v4u ga[2][2], gb[2][2];
#pragma unroll
            for (int m = 0; m < 2; ++m)
#pragma unroll
                for (int bj = 0; bj < 2; ++bj) { const bf16* q = zp + (size_t)(row0 + ai * HALF + (m0 + m) * 16) * ZC + bj * HALF; ga[m][bj] = *(const v4u*)q; gb[m][bj] = *(const v4u*)(q + D); }
#pragma unroll
            for (int m = 0; m < 2; ++m)
#pragma unroll
                for (int bj = 0; bj < 2; ++bj) { float a[8], b[8]; unpack8(ga[m][bj], a); unpack8(gb[m][bj], b);
#pragma unroll
                    for (int i = 0; i < 8; ++i) { const float ea = __builtin_amdgcn_exp2f(fmaxf(a[i], -60.f) * -1.44269504f), eb = __builtin_amdgcn_exp2f(fmaxf(b[i], -60.f) * -1.44269504f);
                        acc[ai][bj][m0 + m][i >> 2][i & 3] *= (1.f + eb) * __builtin_amdgcn_rcpf(1.f + ea); } }
            asm volatile("" ::: "memory"); }
    }
    __device__ __forceinline__ void operator()(const f32x4 (&acc)[2][2][4][2], const Unit& u, int wr, int wc, int fr, int fq) const {
        const int row0 = u.pm * BM + wr * 64 + fr, col0 = u.pn * BM + wc * 32 + 8 * fq;
#pragma unroll
        for (int ai = 0; ai < 2; ++ai) { v4u gg[4][2];
#pragma unroll
            for (int m = 0; m < 4; ++m)
#pragma unroll
                for (int bj = 0; bj < 2; ++bj) gg[m][bj] = *(const v4u*)(Z + (size_t)(row0 + ai * HALF + m * 16) * ZC + ZC_GATE + 3 * D + col0 + bj * HALF);
#pragma unroll
            for (int m = 0; m < 4; ++m)
#pragma unroll
                for (int bj = 0; bj < 2; ++bj) { const size_t row = (size_t)(row0 + ai * HALF + m * 16); const int col = col0 + bj * HALF; float gl[8]; unpack8(gg[m][bj], gl);
                    f32x4 v0 = acc[ai][bj][m][0], v1 = acc[ai][bj][m][1];
#pragma unroll
                    for (int j = 0; j < 4; ++j) { v0[j] *= sigmoidf_(gl[j]) * MGSC; v1[j] *= sigmoidf_(gl[4 + j]) * MGSC; }
                    unsigned w0 = 0, w1 = 0; w0 = __builtin_amdgcn_cvt_pk_fp8_f32(v0[0], v0[1], w0, false); w0 = __builtin_amdgcn_cvt_pk_fp8_f32(v0[2], v0[3], w0, true); w1 = __builtin_amdgcn_cvt_pk_fp8_f32(v1[0], v1[1], w1, false); w1 = __builtin_amdgcn_cvt_pk_fp8_f32(v1[2], v1[3], w1, true);
                    *(v2u*)((unsigned char*)msum + row * D + col) = (v2u){w0, w1}; }
            asm volatile("" ::: "memory"); }
    }
};
struct EpiResid {
    static constexpr bool PERM = true, AFTER_DRAIN = false; static constexpr int MID = 0;
    const void* X; bf16* Y; float sc; bool xbf;
    __device__ __forceinline__ void operator()(const f32x4 (&acc)[2][2][4][2], const Unit& u, int wr, int wc, int fr, int fq) const {
        const int row0 = u.pm * BM + wr * 64 + fr, col0 = u.pn * BM + wc * 32 + 8 * fq;
#pragma unroll
        for (int ai = 0; ai < 2; ++ai)
#pragma unroll
            for (int m = 0; m < 4; ++m) { const size_t off = (size_t)(row0 + ai * HALF + m * 16) * D + col0;
#pragma unroll
                for (int bj = 0; bj < 2; ++bj) { const f32x4 x0 = ld4(X, off + bj * HALF, xbf), x1 = ld4(X, off + bj * HALF + 4, xbf);
                    const f32x4 v0 = x0 * ALPHA + acc[ai][bj][m][0] * sc, v1 = x1 * ALPHA + acc[ai][bj][m][1] * sc;
                    u32x4 w; w.x = pk2(v0[0], v0[1]); w.y = pk2(v0[2], v0[3]); w.z = pk2(v1[0], v1[1]); w.w = pk2(v1[2], v1[3]); *(u32x4*)(Y + off + bj * HALF) = w; } }
    }
};
struct MoeTab {
    LAS int* t; LAS unsigned short* tok; LAS float* wt; LAS unsigned char* mte;
    __device__ __forceinline__ MoeTab(LAS unsigned char* lds) : t((LAS int*)(lds + TAB_OFF)), tok((LAS unsigned short*)(lds + TAB_OFF + 1024)), wt((LAS float*)(lds + TAB_OFF + 5120)), mte((LAS unsigned char*)(lds + TAB_OFF + 13312)) {}
};
__device__ __forceinline__ void moe_tables(const MoeTab& M, const unsigned* cnt  , int tid, int lane, int wave) {
    __syncthreads();
    if (wave == 0) { const int c = (int)cnt[64 * lane]; const int tiles = (c + 255) >> 8; const float incl = wave_scan_incl((float)tiles);
        M.t[80 + lane] = c; M.t[lane] = (int)incl - tiles; if (lane == 63) { M.t[64] = (int)incl; M.t[65] = (int)incl + T / 256; M.t[80 + 64] = T; } }
    __syncthreads();
    const int Mt = M.t[65];
    for (int mt = tid; mt < Mt; mt += 512) { int e = 0;
        for (int k = 1; k <= 64; ++k) e = (M.t[k] <= mt) ? k : e;
        M.mte[mt] = (unsigned char)e; }
    __syncthreads();
}
struct UpOrder {
    MoeTab M; int n;
    __device__ __forceinline__ bool next(int i, Unit& u) const { if (i >= n) return false; u.pm = M.t[168 + i]; u.pn = M.t[176 + i]; u.aux = i; return true; }
    __device__ __forceinline__ int row_token(int i, int r) const { return (int)M.tok[i * 256 + r]; }
    __device__ __forceinline__ void a_ready(const Unit&) const {}
    __device__ __forceinline__ void done(const Unit&) const {}
};
__device__ __forceinline__ int up_order_build(const MoeTab& M, const int* LIST, const float* WL, int wg, int G, int tid) {
    const int U = 4 * M.t[65];
    if (tid < 8) { const int L = tid * G + wg; if (L < U) { const int mt = L >> 2, q = L & 3, e = M.mte[mt]; M.t[168 + tid] = mt; M.t[176 + tid] = e * 4 + q; M.t[184 + tid] = e; M.t[192 + tid] = mt - M.t[e]; } }
    int n = 0;
#pragma unroll
    for (int i = 0; i < 8; ++i) n += (i * G + wg < U) ? 1 : 0;
    __syncthreads();
    for (int idx = tid; idx < n * 256; idx += 512) { const int i = idx >> 8, r = idx & 255, e = M.t[184 + i], li = M.t[192 + i] * 256 + r;
        int tk = 0; float w = 0.f;
        if (e < NE) { if (li < M.t[80 + e]) { tk = LIST[e * T + li]; w = WL[e * T + li]; } } else { tk = li; w = 1.f; }
        M.tok[idx] = (unsigned short)tk; M.wt[idx] = w; }
    __syncthreads();
    return n;
}
struct EpiGluSparse {
    static constexpr bool PERM = true, AFTER_DRAIN = false; static constexpr int MID = 0;
    LAS const float* wt; bf16* H;
    __device__ __forceinline__ void operator()(const f32x4 (&acc)[2][2][4][2], const Unit& u, int wr, int wc, int fr, int fq) const {
        const int q = u.pn & 3; const int rl0 = wr * 64 + fr, col0 = q * 128 + wc * 32 + 8 * fq;
#pragma unroll
        for (int ai = 0; ai < 2; ++ai)
#pragma unroll
            for (int m = 0; m < 4; ++m) { const int rl = rl0 + ai * HALF + m * 16; const float c = wt[u.aux * 256 + rl]; float h[8];
#pragma unroll
                for (int n = 0; n < 2; ++n)
#pragma unroll
                    for (int j = 0; j < 4; ++j) h[4 * n + j] = siluf_(acc[ai][0][m][n][j] * UPSC) * (acc[ai][1][m][n][j] * UPSC) * c;
#if MOE_DN_FP8
#pragma unroll
                for (int j = 0; j < 8; ++j) h[j] = __builtin_amdgcn_fmed3f(h[j] * HSC, -448.f, 448.f);
                unsigned w0 = 0, w1 = 0; w0 = __builtin_amdgcn_cvt_pk_fp8_f32(h[0], h[1], w0, false); w0 = __builtin_amdgcn_cvt_pk_fp8_f32(h[2], h[3], w0, true); w1 = __builtin_amdgcn_cvt_pk_fp8_f32(h[4], h[5], w1, false); w1 = __builtin_amdgcn_cvt_pk_fp8_f32(h[6], h[7], w1, true);
                *(v2u*)((unsigned char*)H + ((size_t)u.pm * 256 + rl) * ED + col0) = (v2u){w0, w1}; }
#else
                u32x4 w; w.x = pk2(h[0], h[1]); w.y = pk2(h[2], h[3]); w.z = pk2(h[4], h[5]); w.w = pk2(h[6], h[7]);
                *(u32x4*)(H + ((size_t)u.pm * 256 + rl) * ED + col0) = w; }
#endif
    }
};
struct DownOrder {
    MoeTab M; int G, c, U;
    __device__ __forceinline__ bool next(int i, Unit& u) const { const int L = i * G + c; if (L >= U) return false; const int mt = L >> 3; u.pm = mt; u.pn = (int)M.mte[mt] * 8 + (L & 7); u.aux = 0; return true; }
    __device__ __forceinline__ void a_ready(const Unit&) const {}
    __device__ __forceinline__ void done(const Unit&) const {}
};
struct EpiYexp {
    static constexpr bool PERM = true, AFTER_DRAIN = false; static constexpr int MID = 0;
    bf16* Y;
    __device__ __forceinline__ void operator()(const f32x4 (&acc)[2][2][4][2], const Unit& u, int wr, int wc, int fr, int fq) const {
        const int row0 = u.pm * BM + wr * 64 + fr, col0 = (u.pn & 7) * BM + wc * 32 + 8 * fq;
#pragma unroll
        for (int ai = 0; ai < 2; ++ai)
#pragma unroll
            for (int m = 0; m < 4; ++m) { bf16* rowp = Y + (size_t)(row0 + ai * HALF + m * 16) * D + col0;
#pragma unroll
                for (int bj = 0; bj < 2; ++bj) { const f32x4 v0 = acc[ai][bj][m][0] * DNSC, v1 = acc[ai][bj][m][1] * DNSC;
                    u32x4 w; w.x = pk2(v0[0], v0[1]); w.y = pk2(v0[2], v0[3]); w.z = pk2(v1[0], v1[1]); w.w = pk2(v1[2], v1[3]); *(u32x4*)(rowp + bj * HALF) = w; } }
    }
};

struct TrItem { const float* src; bf16* dst; unsigned sld, dld; int f8; };
__device__ __forceinline__ void tr_load(const TrItem& t, int lane, v4f (&v)[8]) { const int r8 = lane >> 3, c4 = lane & 7;
#pragma unroll
    for (int i = 0; i < 8; ++i) v[i] = *(const v4f*)(t.src + (size_t)(8 * i + r8) * t.sld + 4 * c4); }
__device__ __forceinline__ void tr_store(const TrItem& t, const v4f (&v)[8], LAS float* scr, int lane, bool nostore = false) {
    { const int r8 = lane >> 3, c4 = lane & 7;
#pragma unroll
      for (int i = 0; i < 8; ++i) { LAS float* d = scr + (8 * i + r8) * 33 + 4 * c4; d[0] = v[i].x; d[1] = v[i].y; d[2] = v[i].z; d[3] = v[i].w; } }
    LDS_WAIT(); asm volatile("" ::: "memory");
    if (nostore) return;
    if (t.f8) {
        const int c = lane & 3;
#pragma unroll
        for (int j = 0; j < 2; ++j) { const int n = (lane >> 2) + 16 * j; const LAS float* s = scr + (16 * c) * 33 + n; unsigned w[4];
#pragma unroll
            for (int q = 0; q < 4; ++q) { unsigned x = 0; x = __builtin_amdgcn_cvt_pk_fp8_f32(s[(4 * q) * 33] * 64.f, s[(4 * q + 1) * 33] * 64.f, x, false); x = __builtin_amdgcn_cvt_pk_fp8_f32(s[(4 * q + 2) * 33] * 64.f, s[(4 * q + 3) * 33] * 64.f, x, true); w[q] = x; }
            *(v4u*)((unsigned char*)t.dst + (size_t)n * t.dld + 16 * c) = (v4u){w[0], w[1], w[2], w[3]}; }
    } else {
        const int c = lane & 7;
#pragma unroll
        for (int j = 0; j < 4; ++j) { const int n = (lane >> 3) + 8 * j; const LAS float* s = scr + (8 * c) * 33 + n;
            v4u o; o.x = pk2(s[0 * 33], s[1 * 33]); o.y = pk2(s[2 * 33], s[3 * 33]); o.z = pk2(s[4 * 33], s[5 * 33]); o.w = pk2(s[6 * 33], s[7 * 33]);
            *(v4u*)(t.dst + (size_t)n * t.dld + 8 * c) = o; }
    }
    LDS_WAIT(); asm volatile("" ::: "memory");
}
template <int PART> __device__ __forceinline__ TrItem tr_decode(const Params& p, int l, int it) {
    unsigned char* ws = p.ws;
    constexpr int N_IN = (ZC / 32) * (D / 64), N_BR = 4 * (BW / 64) * (D / 32), N_OUT = (D / 64) * (D / 32), N_UP = NEX * 2 * (D / 64) * (ED / 32);
    int r = it; TrItem t; t.f8 = 0;
    if (PART == 0) {
        const float* w_in = p.in[I_WIN] + (size_t)l * D * INC; const float* w_br = p.in[I_WBR] + (size_t)l * 4 * BW * D; const float* w_out = p.in[I_WOUT] + (size_t)l * D * D;
        bf16* WIN = (bf16*)(ws + WS_WIN); bf16* WBR = (bf16*)(ws + WS_WBR); bf16* WOUT = (bf16*)(ws + WS_WOUT);
        if (r < N_IN) { const int kb = r / (ZC / 32), n0 = (r % (ZC / 32)) * 32, k0 = kb * 64; const int sc = n0 + (n0 >= ZC_GATE ? 16 : (n0 >= ZC_MLQ ? 8 : 0));
            t.src = w_in + (size_t)k0 * INC + sc; t.sld = INC; t.dst = (bf16*)((unsigned char*)WIN + (size_t)n0 * D + k0); t.dld = D; t.f8 = 1; return t; } r -= N_IN;
        if (r < N_BR) { const int g = r / 512, rr = r % 512, k0 = (rr / 64) * 64, n0 = (rr % 64) * 32;
            t.src = w_br + ((size_t)g * BW + k0) * D + n0; t.sld = D;
#if MERGE_FP8
            t.dst = (bf16*)((unsigned char*)WBR + (size_t)n0 * BRW + g * BW + k0); t.dld = BRW; t.f8 = 1; return t; }
#else
            t.dst = WBR + (size_t)n0 * BRW + g * BW + k0; t.dld = BRW; return t; }
#endif
        r -= N_BR;
        { const int k0 = (r / 64) * 64, n0 = (r % 64) * 32; t.src = w_out + (size_t)k0 * D + n0; t.sld = D; t.dst = (bf16*)((unsigned char*)WOUT + (size_t)n0 * D + k0); t.dld = D; t.f8 = 1; return t; }
    } else {
        const float* w_g = p.in[I_WG] + (size_t)l * NE * D * ED; const float* w_u = p.in[I_WU] + (size_t)l * NE * D * ED; const float* w_d = p.in[I_WD] + (size_t)l * NE * ED * D;
        const float* s_g = p.in[I_SG] + (size_t)l * D * ED; const float* s_u = p.in[I_SU] + (size_t)l * D * ED; const float* s_d = p.in[I_SD] + (size_t)l * ED * D;
        bf16* WUP = (bf16*)(ws + WS_WUP); bf16* WDN = (bf16*)(ws + WS_WDN);
        if (r < N_UP) { const int e = r / 1024, rr = r % 1024, mat = rr / 512, r2 = rr % 512, k0 = (r2 / 16) * 64, n0 = (r2 % 16) * 32;
            const float* sb = (e < NE) ? ((mat ? w_u : w_g) + (size_t)e * D * ED) : (mat ? s_u : s_g);
            const int drow = e * 1024 + (n0 / 128) * 256 + mat * 128 + (n0 % 128);
            t.src = sb + (size_t)k0 * ED + n0; t.sld = ED;
#if MOE_UP_FP8
            t.dst = (bf16*)((unsigned char*)WUP + (size_t)drow * D + k0); t.dld = D; t.f8 = 1; return t; }
#else
            t.dst = WUP + (size_t)drow * D + k0; t.dld = D; return t; }
#endif
        r -= N_UP;
        { const int e = r / 512, rr = r % 512, k0 = (rr / 64) * 64, n0 = (rr % 64) * 32;
            const float* sb = (e < NE) ? (w_d + (size_t)e * ED * D) : s_d;
            t.src = sb + (size_t)k0 * D + n0; t.sld = D;
#if MOE_DN_FP8
            t.dst = (bf16*)((unsigned char*)WDN + ((size_t)e * D + n0) * ED + k0); t.dld = ED; t.f8 = 1; return t; }
#else
            t.dst = WDN + ((size_t)e * D + n0) * ED + k0; t.dld = ED; return t; }
#endif
    }
}
template <int PART> __device__ __forceinline__ void phase_convert(const Params& p, int l, LAS unsigned char* lds, int gw, int NGW, int wave, int lane, bool nostore = false) {
    constexpr int N_IN = (ZC / 32) * (D / 64), N_BR = 4 * (BW / 64) * (D / 32), N_OUT = (D / 64) * (D / 32), N_UP = NEX * 2 * (D / 64) * (ED / 32), N_DN = NEX * (ED / 64) * (D / 32);
    constexpr int NITEMS = (PART == 0) ? (N_IN + N_BR + N_OUT) : (N_UP + N_DN);
    LAS float* scr = (LAS float*)(lds + wave * 16384);
    if (gw >= NITEMS) return;
    TrItem cur = tr_decode<PART>(p, l, gw); v4f va[8], vb[8];
    tr_load(cur, lane, va);
    for (int it = gw; it < NITEMS; it += 2 * NGW) {
        const int i1 = it + NGW, i2 = it + 2 * NGW; TrItem nx = cur;
        if (i1 < NITEMS) { nx = tr_decode<PART>(p, l, i1); } tr_load(nx, lane, vb);
        tr_store(cur, va, scr, lane, nostore);
        if (i1 >= NITEMS) break;
        cur = nx; if (i2 < NITEMS) { cur = tr_decode<PART>(p, l, i2); } tr_load(cur, lane, va);
        tr_store(nx, vb, scr, lane, nostore);
        if (i2 >= NITEMS) break;
    }
}
__device__ __forceinline__ void phase_xprep(const Params& p, int l, const void* xin, bool xbf, LAS unsigned char* lds, int gw, int NGW, int tid, int lane) {
    const float* w_in = p.in[I_WIN] + (size_t)l * D * INC;
    constexpr int XP = 2052; LAS float* xt = (LAS float*)lds; LAS float* part = (LAS float*)lds;
    const int wave = tid >> 6, n_l = lane & 15, kq = lane >> 4, wg = gw >> 3, G = NGW >> 3;
    const int colw = n_l < 8 ? 4608 + n_l : 6152 + (n_l - 8);
    float bw[64];
#pragma unroll
    for (int q = 0; q < 64; ++q) bw[q] = w_in[(size_t)(256 * wave + 16 * (q >> 2) + 4 * kq + (q & 3)) * INC + colw];
    unsigned char* XB = p.ws + WS_XB; float* SMALL = (float*)(p.ws + WS_SMALL);
    __syncthreads();
    for (int tg = wg; tg < T / 16; tg += G) {
        {   v4f va[8], vb[8]; const size_t m0 = (size_t)tg * 16 + 2 * wave;
#pragma unroll
            for (int j = 0; j < 8; ++j) { va[j] = ld4(xin, m0 * D + 4 * lane + 256 * j, xbf); vb[j] = ld4(xin, (m0 + 1) * D + 4 * lane + 256 * j, xbf); }
#pragma unroll
            for (int rr = 0; rr < 2; ++rr) { unsigned* xo = (unsigned*)(XB + (m0 + rr) * D) + lane;
#pragma unroll
                for (int j = 0; j < 8; ++j) { const v4f v = rr ? vb[j] : va[j]; unsigned w = 0; w = __builtin_amdgcn_cvt_pk_fp8_f32(v.x, v.y, w, false); w = __builtin_amdgcn_cvt_pk_fp8_f32(v.z, v.w, w, true); xo[64 * j] = w;
                    *(LAS v4f*)(xt + (2 * wave + rr) * XP + 4 * lane + 256 * j) = v; } } }
        __syncthreads();
        {   pg8::f32x4 acc[4];
#pragma unroll
            for (int i = 0; i < 4; ++i) acc[i] = (pg8::f32x4){0.f, 0.f, 0.f, 0.f};
            const LAS float* xa = xt + n_l * XP + 256 * wave + 4 * kq;
#pragma unroll
            for (int s2 = 0; s2 < 16; ++s2) { const v4f a4 = *(const LAS v4f*)(xa + 16 * s2);
                acc[0] = __builtin_amdgcn_mfma_f32_16x16x4f32(a4.x, bw[4 * s2 + 0], acc[0], 0, 0, 0); acc[1] = __builtin_amdgcn_mfma_f32_16x16x4f32(a4.y, bw[4 * s2 + 1], acc[1], 0, 0, 0);
                acc[2] = __builtin_amdgcn_mfma_f32_16x16x4f32(a4.z, bw[4 * s2 + 2], acc[2], 0, 0, 0); acc[3] = __builtin_amdgcn_mfma_f32_16x16x4f32(a4.w, bw[4 * s2 + 3], acc[3], 0, 0, 0); }
            const pg8::f32x4 tot = (acc[0] + acc[1]) + (acc[2] + acc[3]);
            __syncthreads();
#pragma unroll
            for (int j = 0; j < 4; ++j) part[(wave * 16 + 4 * kq + j) * 16 + n_l] = tot[j]; }
        __syncthreads();
        if (tid < 256) { float a = 0.f;
#pragma unroll
            for (int w = 0; w < 8; ++w) a += part[w * 256 + tid];
            SMALL[(size_t)tg * 256 + tid] = a; }
        __syncthreads();
    }
}


typedef short bf16x8_t __attribute__((ext_vector_type(8)));
__device__ __forceinline__ void ml_pre_item(const Params& p, int l, LAS unsigned char* lds, int item, int tid, int wave, int lane) {
    const int h = item & 3, n = item >> 2; const size_t t0 = (size_t)n * 64;
    const bf16* Z = (const bf16*)(p.ws + WS_Z); const float* SMALL = (const float*)(p.ws + WS_SMALL);
    bf16* MQ = (bf16*)(p.ws + WS_MQ) + (size_t)item * 4096; bf16* MS = (bf16*)(p.ws + WS_MS) + (size_t)item * 4096; bf16* MK = (bf16*)(p.ws + WS_MK) + (size_t)item * 4096;
    bf16* MV = (bf16*)(p.ws + WS_MV) + (size_t)item * 9216; float* MFL = (float*)(p.ws + WS_MFL);
    LAS float* qs = (LAS float*)lds;
    LAS float* ks = qs + 64 * 65;
    LAS float* bs = ks + 64 * 65;
    LAS unsigned short* vs = (LAS unsigned short*)(bs + 128);
    { const int tk = tid >> 3, c8 = tid & 7; float f[8];
      unpack8(*(const v4u*)(Z + (t0 + tk) * ZC + ZC_MLQ + h * 64 + 8 * c8), f);
#pragma unroll
      for (int i = 0; i < 8; ++i) qs[tk * 65 + 8 * c8 + i] = f[i];
      unpack8(*(const v4u*)(Z + (t0 + tk) * ZC + ZC_MLK + h * 64 + 8 * c8), f);
#pragma unroll
      for (int i = 0; i < 8; ++i) ks[tk * 65 + 8 * c8 + i] = f[i]; }
#pragma unroll
    for (int r = 0; r < 2; ++r) { const int idx = tid + 512 * r, tk = idx >> 4, c8 = idx & 15;
        *(LAS v4u*)(vs + tk * 136 + 8 * c8) = *(const v4u*)(Z + (t0 + tk) * ZC + ZC_MLV + h * 128 + 8 * c8); }
    if (wave == 0) { const float fp = SMALL[(t0 + lane) * 16 + 12 + h] + p.in[I_MLFB][l * 4 + h]; const float lf = -softplusf_(-fp);
        bs[lane] = wave_scan_incl(lf); bs[64 + lane] = SMALL[(t0 + lane) * 16 + 8 + h] + p.in[I_MLIB][l * 4 + h]; }
    __syncthreads();
    const float blast = bs[63];
    { const int i = tid >> 3, jb = tid & 7; const float bi = bs[i];
      { const float e = __expf(bi) * 0.125f; float o[8];
#pragma unroll
        for (int x = 0; x < 8; ++x) o[x] = qs[i * 65 + 8 * jb + x] * e;
        v4u w; w.x = pk2(o[0], o[1]); w.y = pk2(o[2], o[3]); w.z = pk2(o[4], o[5]); w.w = pk2(o[6], o[7]); *(v4u*)(MQ + i * 64 + 8 * jb) = w; }
      {
          const int ti = wave >> 1, c16 = lane & 15, g4 = lane >> 4, i2 = 16 * ti + c16; const float bi2 = bs[i2];
#define ML_F8(dst, base) do { const LAS float* _b = (base); const v4u _w = (v4u){pg8::cvt_pk_bf16(_b[0], _b[1]), pg8::cvt_pk_bf16(_b[2], _b[3]), pg8::cvt_pk_bf16(_b[4], _b[5]), pg8::cvt_pk_bf16(_b[6], _b[7])}; dst = __builtin_bit_cast(bf16x8_t, _w); } while (0)
          bf16x8_t bq[2];
#pragma unroll
          for (int s2 = 0; s2 < 2; ++s2) ML_F8(bq[s2], qs + i2 * 65 + 32 * s2 + 8 * g4);
#pragma unroll
          for (int jj = 0; jj < 2; ++jj) { const int tj = 2 * (wave & 1) + jj; v2u sw = (v2u){0u, 0u};
              if (tj <= ti) { pg8::f32x4 d = {0.f, 0.f, 0.f, 0.f};
#pragma unroll
                  for (int s2 = 0; s2 < 2; ++s2) { bf16x8_t a; ML_F8(a, ks + (16 * tj + c16) * 65 + 32 * s2 + 8 * g4); d = __builtin_amdgcn_mfma_f32_16x16x32_bf16(a, bq[s2], d, 0, 0, 0); }
                  float v4[4];
#pragma unroll
                  for (int r = 0; r < 4; ++r) { const int j = 16 * tj + 4 * g4 + r; v4[r] = (j <= i2) ? __expf(bi2 - bs[j] + bs[64 + j]) * d[r] * 0.125f : 0.f; }
                  sw = (v2u){pk2(v4[0], v4[1]), pk2(v4[2], v4[3])}; }
              *(v2u*)(MS + i2 * 64 + 16 * tj + 4 * g4) = sw; }
#undef ML_F8
      }
      { float o[8];
#pragma unroll
        for (int x = 0; x < 8; ++x) { const int j = 8 * jb + x; o[x] = ks[j * 65 + i] * __expf(blast - bs[j] + bs[64 + j]); }
        v4u w; w.x = pk2(o[0], o[1]); w.y = pk2(o[2], o[3]); w.z = pk2(o[4], o[5]); w.w = pk2(o[6], o[7]); *(v4u*)(MK + i * 64 + 8 * jb) = w; }
    }
    { const int c = tid >> 2, jq = tid & 3; unsigned w[8];
#pragma unroll
      for (int x = 0; x < 8; ++x) w[x] = (unsigned)vs[(16 * jq + 2 * x) * 136 + c] | ((unsigned)vs[(16 * jq + 2 * x + 1) * 136 + c] << 16);
      *(v4u*)(MV + c * 64 + 16 * jq) = (v4u){w[0], w[1], w[2], w[3]}; *(v4u*)(MV + c * 64 + 16 * jq + 8) = (v4u){w[4], w[5], w[6], w[7]};
      if (tid < 64) { const int c2 = 128 + (tid >> 2); const unsigned one = (c2 == 128) ? 0x3F803F80u : 0u;
          *(v4u*)(MV + c2 * 64 + 16 * jq) = (v4u){one, one, one, one}; *(v4u*)(MV + c2 * 64 + 16 * jq + 8) = (v4u){one, one, one, one}; } }
    if (tid == 0) MFL[item] = __expf(blast);
    __syncthreads();
}
struct MlFrags { bf16x8_t q[2], s[2], kt[2], vt[2]; float fl; };
__device__ __forceinline__ void ml_load(MlFrags& F, const Params& p, int item, int offA, int offV) {
    const bf16* MQ = (const bf16*)(p.ws + WS_MQ) + (size_t)item * 4096; const bf16* MS = (const bf16*)(p.ws + WS_MS) + (size_t)item * 4096; const bf16* MK = (const bf16*)(p.ws + WS_MK) + (size_t)item * 4096;
    const bf16* MV = (const bf16*)(p.ws + WS_MV) + (size_t)item * 9216;
#pragma unroll
    for (int ks = 0; ks < 2; ++ks) { F.q[ks] = *(const bf16x8_t*)(MQ + offA + 32 * ks); F.s[ks] = *(const bf16x8_t*)(MS + offA + 32 * ks); F.kt[ks] = *(const bf16x8_t*)(MK + offA + 32 * ks); F.vt[ks] = *(const bf16x8_t*)(MV + offV + 32 * ks); }
    F.fl = ((const float*)(p.ws + WS_MFL))[item];
}
__device__ __forceinline__ void ml_seq(const Params& p, LAS unsigned char* lds, int wgi, int wave, int lane) {
    const int u = wgi * 2 + (wave >> 2), wi = wave & 3, h = u / 9, sl = u % 9, g = lane >> 4, c = lane & 15;
    LAS unsigned short* CT = (LAS unsigned short*)(lds + (wave >> 2) * 4096);
    float* HO = (float*)(p.ws + WS_HO); float* HDEN = (float*)(p.ws + WS_HDEN);
    const int offA = (16 * wi + c) * 64 + 8 * g, offV = (16 * sl + c) * 64 + 8 * g;
    *(LAS v2u*)(CT + c * 64 + 16 * wi + 4 * g) = (v2u){0u, 0u};
    pg8::f32x4 Cacc = {0.f, 0.f, 0.f, 0.f};
    __syncthreads();
    MlFrags F0, F1;
    ml_load(F0, p, h, offA, offV);
#define ML_STEP(F, n_) do { const int cur = (n_) & 1; \
        const bf16x8_t c0 = *(const LAS bf16x8_t*)(CT + cur * 1024 + c * 64 + 8 * g), c1 = *(const LAS bf16x8_t*)(CT + cur * 1024 + c * 64 + 32 + 8 * g); \
        pg8::f32x4 num = {0.f, 0.f, 0.f, 0.f}; \
        num = __builtin_amdgcn_mfma_f32_16x16x32_bf16(F.q[0], c0, num, 0, 0, 0); num = __builtin_amdgcn_mfma_f32_16x16x32_bf16(F.q[1], c1, num, 0, 0, 0); \
        num = __builtin_amdgcn_mfma_f32_16x16x32_bf16(F.s[0], F.vt[0], num, 0, 0, 0); num = __builtin_amdgcn_mfma_f32_16x16x32_bf16(F.s[1], F.vt[1], num, 0, 0, 0); \
        Cacc = Cacc * F.fl; \
        Cacc = __builtin_amdgcn_mfma_f32_16x16x32_bf16(F.kt[0], F.vt[0], Cacc, 0, 0, 0); Cacc = __builtin_amdgcn_mfma_f32_16x16x32_bf16(F.kt[1], F.vt[1], Cacc, 0, 0, 0); \
        { v2u w; w.x = pk2(Cacc[0], Cacc[1]); w.y = pk2(Cacc[2], Cacc[3]); *(LAS v2u*)(CT + (cur ^ 1) * 1024 + c * 64 + 16 * wi + 4 * g) = w; } \
        { const size_t tb = (size_t)(n_) * 64 + 16 * wi + 4 * g; \
          if (sl < 8) { _Pragma("unroll") for (int r = 0; r < 4; ++r) HO[(tb + r) * BW + h * 128 + 16 * sl + c] = num[r]; } \
          else if (c == 0) { _Pragma("unroll") for (int r = 0; r < 4; ++r) HDEN[(tb + r) * 4 + h] = num[r]; } } \
        LDS_BAR(); } while (0)
    for (int n = 0; n < T / 64; n += 2) {
        ml_load(F1, p, (n + 1) * 4 + h, offA, offV);
        ML_STEP(F0, n);
        ml_load(F0, p, ((n + 2 < T / 64) ? n + 2 : n) * 4 + h, offA, offV);
        ML_STEP(F1, n + 1);
    }
#undef ML_STEP
}


constexpr int QP = 132;
__device__ __forceinline__ void gdn_pre_item(const Params& p, int l, LAS unsigned char* lds, int item, int tid, int wave, int lane) {
    const int h = item & 3, n = item >> 2; const size_t t0 = (size_t)n * 64;
    const bf16* Z = (const bf16*)(p.ws + WS_Z); const float* SMALL = (const float*)(p.ws + WS_SMALL);
    float* GU = (float*)(p.ws + WS_GU) + (size_t)item * 8192; bf16* GNW = (bf16*)(p.ws + WS_GNW) + (size_t)item * 8192; bf16* GQG = (bf16*)(p.ws + WS_GQG) + (size_t)item * 8192;
    bf16* GAT = (bf16*)(p.ws + WS_GAT) + (size_t)item * 4096; bf16* GKT = (bf16*)(p.ws + WS_GKT) + (size_t)item * 8192; float* GDL = (float*)(p.ws + WS_GDL);
    const float* cw = p.in[I_CONVW] + (size_t)l * 4 * 1536;
    LAS float* qs = (LAS float*)lds; LAS float* ks = qs + 64 * QP; LAS float* vs = ks + 64 * QP; LAS float* Ls = vs + 64 * QP;   LAS float* gcs = Ls + 64 * 68; LAS float* bts = gcs + 64; LAS float* btg = bts + 64;
    LAS unsigned short* zq = (LAS unsigned short*)(lds + 131584); LAS unsigned short* zk = (LAS unsigned short*)Ls; LAS unsigned short* zv = (LAS unsigned short*)vs; LAS float* cwl = btg + 64;
    float gate_b = 0.f, gate_a = 0.f; if (wave == 0) { gate_b = SMALL[(t0 + lane) * 16 + h]; gate_a = SMALL[(t0 + lane) * 16 + 4 + h]; }
    {   v4u zr[7]; v4f wr4 = (v4f){0.f, 0.f, 0.f, 0.f};
#pragma unroll
        for (int q = 0; q < 7; ++q) { const int idx = tid + 512 * q; zr[q] = (v4u){0u, 0u, 0u, 0u};
            if (idx < 3216) { const int seg = idx / 1072, rem = idx % 1072, r = rem >> 4, c16 = rem & 15; const long tt = (long)t0 - 3 + r;
                if (tt >= 0) zr[q] = *(const v4u*)(Z + (size_t)tt * ZC + ZC_GDN + seg * 512 + h * 128 + 8 * c16); } }
        if (tid < 384) { const int j = tid / 96, rest = tid % 96, i = rest >> 5, c4 = rest & 31; wr4 = *(const v4f*)(cw + j * 1536 + i * 512 + h * 128 + 4 * c4); }
#pragma unroll
        for (int q = 0; q < 7; ++q) { const int idx = tid + 512 * q;
            if (idx < 3216) { const int seg = idx / 1072, rem = idx % 1072; LAS unsigned short* zb = seg == 0 ? zq : (seg == 1 ? zk : zv); *(LAS v4u*)(zb + 8 * rem) = zr[q]; } }
        if (tid < 384) *(LAS v4f*)(cwl + 4 * tid) = wr4;
    }
    __syncthreads();
    { const int tk = tid >> 3, part = tid & 7; float av[16];
#pragma unroll 1
      for (int i = 0; i < 3; ++i) { float a[16]; const LAS unsigned short* zb = i == 0 ? zq : (i == 1 ? zk : zv);
#pragma unroll
        for (int x = 0; x < 16; ++x) a[x] = 0.f;
#pragma unroll
        for (int j = 0; j < 4; ++j) { const LAS unsigned short* src = zb + (tk + j) * 128 + 16 * part; float x0[8], x1[8]; unpack8(*(const LAS v4u*)src, x0); unpack8(*(const LAS v4u*)(src + 8), x1);
            const LAS float* wp = cwl + (j * 3 + i) * 128 + 16 * part;
#pragma unroll
            for (int x4 = 0; x4 < 2; ++x4) { const v4f w0 = *(const LAS v4f*)(wp + 4 * x4), w1 = *(const LAS v4f*)(wp + 8 + 4 * x4);
                a[4 * x4] += w0.x * x0[4 * x4]; a[4 * x4 + 1] += w0.y * x0[4 * x4 + 1]; a[4 * x4 + 2] += w0.z * x0[4 * x4 + 2]; a[4 * x4 + 3] += w0.w * x0[4 * x4 + 3];
                a[8 + 4 * x4] += w1.x * x1[4 * x4]; a[8 + 4 * x4 + 1] += w1.y * x1[4 * x4 + 1]; a[8 + 4 * x4 + 2] += w1.z * x1[4 * x4 + 2]; a[8 + 4 * x4 + 3] += w1.w * x1[4 * x4 + 3]; } }
        float ss = 0.f;
#pragma unroll
        for (int x = 0; x < 16; ++x) { a[x] = siluf_(a[x]); ss += a[x] * a[x]; }
        if (i < 2) { ss = sum8(ss); const float r = rsqrtf(ss + 1e-6f) * (i == 0 ? 0.08838834764831845f : 1.f);
#pragma unroll
            for (int x = 0; x < 16; ++x) a[x] *= r;
            LAS float* dst = (i == 0 ? qs : ks) + tk * QP + 16 * part;
#pragma unroll
            for (int x4 = 0; x4 < 4; ++x4) *(LAS v4f*)(dst + 4 * x4) = (v4f){a[4 * x4], a[4 * x4 + 1], a[4 * x4 + 2], a[4 * x4 + 3]}; }
        else {
#pragma unroll
            for (int x = 0; x < 16; ++x) av[x] = a[x]; } }
      __syncthreads();
      { LAS float* dst = vs + tk * QP + 16 * part;
#pragma unroll
        for (int x4 = 0; x4 < 4; ++x4) *(LAS v4f*)(dst + 4 * x4) = (v4f){av[4 * x4], av[4 * x4 + 1], av[4 * x4 + 2], av[4 * x4 + 3]}; } }
    if (wave == 0) { const float bb = gate_b, aa = gate_a;
        const float g = -__expf(p.in[I_ALOG][l * 4 + h]) * softplusf_(aa + p.in[I_DTB][l * 4 + h]);
        const float gc = wave_scan_incl(g), bt = sigmoidf_(bb); gcs[lane] = gc; bts[lane] = bt; btg[lane] = bt * __expf(gc); }
    __syncthreads();
    { const int ti = wave >> 1, c16 = lane & 15, g4 = lane >> 4, i = 16 * ti + c16; const float gi = gcs[i], bi = bts[i];
#define GDN_F8(dst, base) do { const v4f _a = *(const LAS v4f*)(base), _b = *(const LAS v4f*)((base) + 4); const v4u _w = (v4u){pg8::cvt_pk_bf16(_a.x, _a.y), pg8::cvt_pk_bf16(_a.z, _a.w), pg8::cvt_pk_bf16(_b.x, _b.y), pg8::cvt_pk_bf16(_b.z, _b.w)}; dst = __builtin_bit_cast(bf16x8_t, _w); } while (0)
      bf16x8_t bk[4], bq[4];
#pragma unroll
      for (int s4 = 0; s4 < 4; ++s4) { GDN_F8(bk[s4], ks + i * QP + 32 * s4 + 8 * g4); GDN_F8(bq[s4], qs + i * QP + 32 * s4 + 8 * g4); }
#pragma unroll
      for (int jj = 0; jj < 2; ++jj) { const int tj = 2 * (wave & 1) + jj; v4f lv = (v4f){0.f, 0.f, 0.f, 0.f}; v2u aw = (v2u){0u, 0u};
          if (tj <= ti) { pg8::f32x4 dk = {0.f, 0.f, 0.f, 0.f}, dq = {0.f, 0.f, 0.f, 0.f};
#pragma unroll
              for (int s4 = 0; s4 < 4; ++s4) { bf16x8_t a; GDN_F8(a, ks + (16 * tj + c16) * QP + 32 * s4 + 8 * g4);
                  dk = __builtin_amdgcn_mfma_f32_16x16x32_bf16(a, bk[s4], dk, 0, 0, 0); dq = __builtin_amdgcn_mfma_f32_16x16x32_bf16(a, bq[s4], dq, 0, 0, 0); }
              float l4[4], a4[4];
#pragma unroll
              for (int r = 0; r < 4; ++r) { const int j = 16 * tj + 4 * g4 + r; const float dc = __expf(gi - gcs[j]); l4[r] = (j < i) ? bi * dk[r] * dc : 0.f; a4[r] = (j <= i) ? dq[r] * dc : 0.f; }
              lv = (v4f){l4[0], l4[1], l4[2], l4[3]}; aw = (v2u){pk2(a4[0], a4[1]), pk2(a4[2], a4[3])}; }
          *(LAS v4f*)(Ls + i * 68 + 16 * tj + 4 * g4) = lv; *(v2u*)(GAT + i * 64 + 16 * tj + 4 * g4) = aw; }
#undef GDN_F8
    }
    __syncthreads();
    if (tid < 256) {
        const int c = tid; int vz; asm volatile("v_mov_b32 %0, 0" : "=v"(vz));
        const LAS float* rp = (c < 128) ? (vs + c) : (ks + (c - 128)); const LAS float* mp = ((c < 128) ? bts : btg) + vz;
#define GDN_RHS(i) (rp[(i) * QP] * mp[(i)])
#define GDN_L4(i, j4) (*(const LAS v4f*)(Ls + (i) * 68 + 4 * (j4) + vz))
        float x0 = GDN_RHS(0); __builtin_amdgcn_sched_barrier(0);
        float x1 = GDN_RHS(1); { const v4f l0 = GDN_L4(1, 0); __builtin_amdgcn_sched_barrier(0); x1 -= l0.x * x0; } __builtin_amdgcn_sched_barrier(0);
        float x2 = GDN_RHS(2); { const v4f l0 = GDN_L4(2, 0); __builtin_amdgcn_sched_barrier(0); x2 -= l0.x * x0; x2 -= l0.y * x1; } __builtin_amdgcn_sched_barrier(0);
        float x3 = GDN_RHS(3); { const v4f l0 = GDN_L4(3, 0); __builtin_amdgcn_sched_barrier(0); x3 -= l0.x * x0; x3 -= l0.y * x1; x3 -= l0.z * x2; } __builtin_amdgcn_sched_barrier(0);
        float x4 = GDN_RHS(4); { const v4f l0 = GDN_L4(4, 0); __builtin_amdgcn_sched_barrier(0); x4 -= l0.x * x0; x4 -= l0.y * x1; x4 -= l0.z * x2; x4 -= l0.w * x3; } __builtin_amdgcn_sched_barrier(0);
        float x5 = GDN_RHS(5); { const v4f l0 = GDN_L4(5, 0); const v4f l1 = GDN_L4(5, 1); __builtin_amdgcn_sched_barrier(0); x5 -= l0.x * x0; x5 -= l0.y * x1; x5 -= l0.z * x2; x5 -= l0.w * x3; x5 -= l1.x * x4; } __builtin_amdgcn_sched_barrier(0);
        float x6 = GDN_RHS(6); { const v4f l0 = GDN_L4(6, 0); const v4f l1 = GDN_L4(6, 1); __builtin_amdgcn_sched_barrier(0); x6 -= l0.x * x0; x6 -= l0.y * x1; x6 -= l0.z * x2; x6 -= l0.w * x3; x6 -= l1.x * x4; x6 -= l1.y * x5; } __builtin_amdgcn_sched_barrier(0);
        float x7 = GDN_RHS(7); { const v4f l0 = GDN_L4(7, 0); const v4f l1 = GDN_L4(7, 1); __builtin_amdgcn_sched_barrier(0); x7 -= l0.x * x0; x7 -= l0.y * x1; x7 -= l0.z * x2; x7 -= l0.w * x3; x7 -= l1.x * x4; x7 -= l1.y * x5; x7 -= l1.z * x6; } __builtin_amdgcn_sched_barrier(0);
        float x8 = GDN_RHS(8); { const v4f l0 = GDN_L4(8, 0); const v4f l1 = GDN_L4(8, 1); __builtin_amdgcn_sched_barrier(0); x8 -= l0.x * x0; x8 -= l0.y * x1; x8 -= l0.z * x2; x8 -= l0.w * x3; x8 -= l1.x * x4; x8 -= l1.y * x5; x8 -= l1.z * x6; x8 -= l1.w * x7; } __builtin_amdgcn_sched_barrier(0);
        float x9 = GDN_RHS(9); { const v4f l0 = GDN_L4(9, 0); const v4f l1 = GDN_L4(9, 1); const v4f l2 = GDN_L4(9, 2); __builtin_amdgcn_sched_barrier(0); x9 -= l0.x * x0; x9 -= l0.y * x1; x9 -= l0.z * x2; x9 -= l0.w * x3; x9 -= l1.x * x4; x9 -= l1.y * x5; x9 -= l1.z * x6; x9 -= l1.w * x7; x9 -= l2.x * x8; } __builtin_amdgcn_sched_barrier(0);
        float x10 = GDN_RHS(10); { const v4f l0 = GDN_L4(10, 0); const v4f l1 = GDN_L4(10, 1); const v4f l2 = GDN_L4(10, 2); __builtin_amdgcn_sched_barrier(0); x10 -= l0.x * x0; x10 -= l0.y * x1; x10 -= l0.z * x2; x10 -= l0.w * x3; x10 -= l1.x * x4; x10 -= l1.y * x5; x10 -= l1.z * x6; x10 -= l1.w * x7; x10 -= l2.x * x8; x10 -= l2.y * x9; } __builtin_amdgcn_sched_barrier(0);
        float x11 = GDN_RHS(11); { const v4f l0 = GDN_L4(11, 0); const v4f l1 = GDN_L4(11, 1); const v4f l2 = GDN_L4(11, 2); __builtin_amdgcn_sched_barrier(0); x11 -= l0.x * x0; x11 -= l0.y * x1; x11 -= l0.z * x2; x11 -= l0.w * x3; x11 -= l1.x * x4; x11 -= l1.y * x5; x11 -= l1.z * x6; x11 -= l1.w * x7; x11 -= l2.x * x8; x11 -= l2.y * x9; x11 -= l2.z * x10; } __builtin_amdgcn_sched_barrier(0);
        float x12 = GDN_RHS(12); { const v4f l0 = GDN_L4(12, 0); const v4f l1 = GDN_L4(12, 1); const v4f l2 = GDN_L4(12, 2); __builtin_amdgcn_sched_barrier(0); x12 -= l0.x * x0; x12 -= l0.y * x1; x12 -= l0.z * x2; x12 -= l0.w * x3; x12 -= l1.x * x4; x12 -= l1.y * x5; x12 -= l1.z * x6; x12 -= l1.w * x7; x12 -= l2.x * x8; x12 -= l2.y * x9; x12 -= l2.z * x10; x12 -= l2.w * x11; } __builtin_amdgcn_sched_barrier(0);
        float x13 = GDN_RHS(13); { const v4f l0 = GDN_L4(13, 0); const v4f l1 = GDN_L4(13, 1); const v4f l2 = GDN_L4(13, 2); const v4f l3 = GDN_L4(13, 3); __builtin_amdgcn_sched_barrier(0); x13 -= l0.x * x0; x13 -= l0.y * x1; x13 -= l0.z * x2; x13 -= l0.w * x3; x13 -= l1.x * x4; x13 -= l1.y * x5; x13 -= l1.z * x6; x13 -= l1.w * x7; x13 -= l2.x * x8; x13 -= l2.y * x9; x13 -= l2.z * x10; x13 -= l2.w * x11; x13 -= l3.x * x12; } __builtin_amdgcn_sched_barrier(0);
        float x14 = GDN_RHS(14); { const v4f l0 = GDN_L4(14, 0); const v4f l1 = GDN_L4(14, 1); const v4f l2 = GDN_L4(14, 2); const v4f l3 = GDN_L4(14, 3); __builtin_amdgcn_sched_barrier(0); x14 -= l0.x * x0; x14 -= l0.y * x1; x14 -= l0.z * x2; x14 -= l0.w * x3; x14 -= l1.x * x4; x14 -= l1.y * x5; x14 -= l1.z * x6; x14 -= l1.w * x7; x14 -= l2.x * x8; x14 -= l2.y * x9; x14 -= l2.z * x10; x14 -= l2.w * x11; x14 -= l3.x * x12; x14 -= l3.y * x13; } __builtin_amdgcn_sched_barrier(0);
        float x15 = GDN_RHS(15); { const v4f l0 = GDN_L4(15, 0); const v4f l1 = GDN_L4(15, 1); const v4f l2 = GDN_L4(15, 2); const v4f l3 = GDN_L4(15, 3); __builtin_amdgcn_sched_barrier(0); x15 -= l0.x * x0; x15 -= l0.y * x1; x15 -= l0.z * x2; x15 -= l0.w * x3; x15 -= l1.x * x4; x15 -= l1.y * x5; x15 -= l1.z * x6; x15 -= l1.w * x7; x15 -= l2.x * x8; x15 -= l2.y * x9; x15 -= l2.z * x10; x15 -= l2.w * x11; x15 -= l3.x * x12; x15 -= l3.y * x13; x15 -= l3.z * x14; } __builtin_amdgcn_sched_barrier(0);
        float x16 = GDN_RHS(16); { const v4f l0 = GDN_L4(16, 0); const v4f l1 = GDN_L4(16, 1); const v4f l2 = GDN_L4(16, 2); const v4f l3 = GDN_L4(16, 3); __builtin_amdgcn_sched_barrier(0); x16 -= l0.x * x0; x16 -= l0.y * x1; x16 -= l0.z * x2; x16 -= l0.w * x3; x16 -= l1.x * x4; x16 -= l1.y * x5; x16 -= l1.z * x6; x16 -= l1.w * x7; x16 -= l2.x * x8; x16 -= l2.y * x9; x16 -= l2.z * x10; x16 -= l2.w * x11; x16 -= l3.x * x12; x16 -= l3.y * x13; x16 -= l3.z * x14; x16 -= l3.w * x15; } __builtin_amdgcn_sched_barrier(0);
        float x17 = GDN_RHS(17); { const v4f l0 = GDN_L4(17, 0); const v4f l1 = GDN_L4(17, 1); const v4f l2 = GDN_L4(17, 2); const v4f l3 = GDN_L4(17, 3); const v4f l4 = GDN_L4(17, 4); __builtin_amdgcn_sched_barrier(0); x17 -= l0.x * x0; x17 -= l0.y * x1; x17 -= l0.z * x2; x17 -= l0.w * x3; x17 -= l1.x * x4; x17 -= l1.y * x5; x17 -= l1.z * x6; x17 -= l1.w * x7; x17 -= l2.x * x8; x17 -= l2.y * x9; x17 -= l2.z * x10; x17 -= l2.w * x11; x17 -= l3.x * x12; x17 -= l3.y * x13; x17 -= l3.z * x14; x17 -= l3.w * x15; x17 -= l4.x * x16; } __builtin_amdgcn_sched_barrier(0);
        float x18 = GDN_RHS(18); { const v4f l0 = GDN_L4(18, 0); const v4f l1 = GDN_L4(18, 1); const v4f l2 = GDN_L4(18, 2); const v4f l3 = GDN_L4(18, 3); const v4f l4 = GDN_L4(18, 4); __builtin_amdgcn_sched_barrier(0); x18 -= l0.x * x0; x18 -= l0.y * x1; x18 -= l0.z * x2; x18 -= l0.w * x3; x18 -= l1.x * x4; x18 -= l1.y * x5; x18 -= l1.z * x6; x18 -= l1.w * x7; x18 -= l2.x * x8; x18 -= l2.y * x9; x18 -= l2.z * x10; x18 -= l2.w * x11; x18 -= l3.x * x12; x18 -= l3.y * x13; x18 -= l3.z * x14; x18 -= l3.w * x15; x18 -= l4.x * x16; x18 -= l4.y * x17; } __builtin_amdgcn_sched_barrier(0);
        float x19 = GDN_RHS(19); { const v4f l0 = GDN_L4(19, 0); const v4f l1 = GDN_L4(19, 1); const v4f l2 = GDN_L4(19, 2); const v4f l3 = GDN_L4(19, 3); const v4f l4 = GDN_L4(19, 4); __builtin_amdgcn_sched_barrier(0); x19 -= l0.x * x0; x19 -= l0.y * x1; x19 -= l0.z * x2; x19 -= l0.w * x3; x19 -= l1.x * x4; x19 -= l1.y * x5; x19 -= l1.z * x6; x19 -= l1.w * x7; x19 -= l2.x * x8; x19 -= l2.y * x9; x19 -= l2.z * x10; x19 -= l2.w * x11; x19 -= l3.x * x12; x19 -= l3.y * x13; x19 -= l3.z * x14; x19 -= l3.w * x15; x19 -= l4.x * x16; x19 -= l4.y * x17; x19 -= l4.z * x18; } __builtin_amdgcn_sched_barrier(0);
        float x20 = GDN_RHS(20); { const v4f l0 = GDN_L4(20, 0); const v4f l1 = GDN_L4(20, 1); const v4f l2 = GDN_L4(20, 2); const v4f l3 = GDN_L4(20, 3); const v4f l4 = GDN_L4(20, 4); __builtin_amdgcn_sched_barrier(0); x20 -= l0.x * x0; x20 -= l0.y * x1; x20 -= l0.z * x2; x20 -= l0.w * x3; x20 -= l1.x * x4; x20 -= l1.y * x5; x20 -= l1.z * x6; x20 -= l1.w * x7; x20 -= l2.x * x8; x20 -= l2.y * x9; x20 -= l2.z * x10; x20 -= l2.w * x11; x20 -= l3.x * x12; x20 -= l3.y * x13; x20 -= l3.z * x14; x20 -= l3.w * x15; x20 -= l4.x * x16; x20 -= l4.y * x17; x20 -= l4.z * x18; x20 -= l4.w * x19; } __builtin_amdgcn_sched_barrier(0);
        float x21 = GDN_RHS(21); { const v4f l0 = GDN_L4(21, 0); const v4f l1 = GDN_L4(21, 1); const v4f l2 = GDN_L4(21, 2); const v4f l3 = GDN_L4(21, 3); const v4f l4 = GDN_L4(21, 4); const v4f l5 = GDN_L4(21, 5); __builtin_amdgcn_sched_barrier(0); x21 -= l0.x * x0; x21 -= l0.y * x1; x21 -= l0.z * x2; x21 -= l0.w * x3; x21 -= l1.x * x4; x21 -= l1.y * x5; x21 -= l1.z * x6; x21 -= l1.w * x7; x21 -= l2.x * x8; x21 -= l2.y * x9; x21 -= l2.z * x10; x21 -= l2.w * x11; x21 -= l3.x * x12; x21 -= l3.y * x13; x21 -= l3.z * x14; x21 -= l3.w * x15; x21 -= l4.x * x16; x21 -= l4.y * x17; x21 -= l4.z * x18; x21 -= l4.w * x19; x21 -= l5.x * x20; } __builtin_amdgcn_sched_barrier(0);
        float x22 = GDN_RHS(22); { const v4f l0 = GDN_L4(22, 0); const v4f l1 = GDN_L4(22, 1); const v4f l2 = GDN_L4(22, 2); const v4f l3 = GDN_L4(22, 3); const v4f l4 = GDN_L4(22, 4); const v4f l5 = GDN_L4(22, 5); __builtin_amdgcn_sched_barrier(0); x22 -= l0.x * x0; x22 -= l0.y * x1; x22 -= l0.z * x2; x22 -= l0.w * x3; x22 -= l1.x * x4; x22 -= l1.y * x5; x22 -= l1.z * x6; x22 -= l1.w * x7; x22 -= l2.x * x8; x22 -= l2.y * x9; x22 -= l2.z * x10; x22 -= l2.w * x11; x22 -= l3.x * x12; x22 -= l3.y * x13; x22 -= l3.z * x14; x22 -= l3.w * x15; x22 -= l4.x * x16; x22 -= l4.y * x17; x22 -= l4.z * x18; x22 -= l4.w * x19; x22 -= l5.x * x20; x22 -= l5.y * x21; } __builtin_amdgcn_sched_barrier(0);
        float x23 = GDN_RHS(23); { const v4f l0 = GDN_L4(23, 0); const v4f l1 = GDN_L4(23, 1); const v4f l2 = GDN_L4(23, 2); const v4f l3 = GDN_L4(23, 3); const v4f l4 = GDN_L4(23, 4); const v4f l5 = GDN_L4(23, 5); __builtin_amdgcn_sched_barrier(0); x23 -= l0.x * x0; x23 -= l0.y * x1; x23 -= l0.z * x2; x23 -= l0.w * x3; x23 -= l1.x * x4; x23 -= l1.y * x5; x23 -= l1.z * x6; x23 -= l1.w * x7; x23 -= l2.x * x8; x23 -= l2.y * x9; x23 -= l2.z * x10; x23 -= l2.w * x11; x23 -= l3.x * x12; x23 -= l3.y * x13; x23 -= l3.z * x14; x23 -= l3.w * x15; x23 -= l4.x * x16; x23 -= l4.y * x17; x23 -= l4.z * x18; x23 -= l4.w * x19; x23 -= l5.x * x20; x23 -= l5.y * x21; x23 -= l5.z * x22; } __builtin_amdgcn_sched_barrier(0);
        float x24 = GDN_RHS(24); { const v4f l0 = GDN_L4(24, 0); const v4f l1 = GDN_L4(24, 1); const v4f l2 = GDN_L4(24, 2); const v4f l3 = GDN_L4(24, 3); const v4f l4 = GDN_L4(24, 4); const v4f l5 = GDN_L4(24, 5); __builtin_amdgcn_sched_barrier(0); x24 -= l0.x * x0; x24 -= l0.y * x1; x24 -= l0.z * x2; x24 -= l0.w * x3; x24 -= l1.x * x4; x24 -= l1.y * x5; x24 -= l1.z * x6; x24 -= l1.w * x7; x24 -= l2.x * x8; x24 -= l2.y * x9; x24 -= l2.z * x10; x24 -= l2.w * x11; x24 -= l3.x * x12; x24 -= l3.y * x13; x24 -= l3.z * x14; x24 -= l3.w * x15; x24 -= l4.x * x16; x24 -= l4.y * x17; x24 -= l4.z * x18; x24 -= l4.w * x19; x24 -= l5.x * x20; x24 -= l5.y * x21; x24 -= l5.z * x22; x24 -= l5.w * x23; } __builtin_amdgcn_sched_barrier(0);
        float x25 = GDN_RHS(25); { const v4f l0 = GDN_L4(25, 0); const v4f l1 = GDN_L4(25, 1); const v4f l2 = GDN_L4(25, 2); const v4f l3 = GDN_L4(25, 3); const v4f l4 = GDN_L4(25, 4); const v4f l5 = GDN_L4(25, 5); const v4f l6 = GDN_L4(25, 6); __builtin_amdgcn_sched_barrier(0); x25 -= l0.x * x0; x25 -= l0.y * x1; x25 -= l0.z * x2; x25 -= l0.w * x3; x25 -= l1.x * x4; x25 -= l1.y * x5; x25 -= l1.z * x6; x25 -= l1.w * x7; x25 -= l2.x * x8; x25 -= l2.y * x9; x25 -= l2.z * x10; x25 -= l2.w * x11; x25 -= l3.x * x12; x25 -= l3.y * x13; x25 -= l3.z * x14; x25 -= l3.w * x15; x25 -= l4.x * x16; x25 -= l4.y * x17; x25 -= l4.z * x18; x25 -= l4.w * x19; x25 -= l5.x * x20; x25 -= l5.y * x21; x25 -= l5.z * x22; x25 -= l5.w * x23; x25 -= l6.x * x24; } __builtin_amdgcn_sched_barrier(0);
        float x26 = GDN_RHS(26); { const v4f l0 = GDN_L4(26, 0); const v4f l1 = GDN_L4(26, 1); const v4f l2 = GDN_L4(26, 2); const v4f l3 = GDN_L4(26, 3); const v4f l4 = GDN_L4(26, 4); const v4f l5 = GDN_L4(26, 5); const v4f l6 = GDN_L4(26, 6); __builtin_amdgcn_sched_barrier(0); x26 -= l0.x * x0; x26 -= l0.y * x1; x26 -= l0.z * x2; x26 -= l0.w * x3; x26 -= l1.x * x4; x26 -= l1.y * x5; x26 -= l1.z * x6; x26 -= l1.w * x7; x26 -= l2.x * x8; x26 -= l2.y * x9; x26 -= l2.z * x10; x26 -= l2.w * x11; x26 -= l3.x * x12; x26 -= l3.y * x13; x26 -= l3.z * x14; x26 -= l3.w * x15; x26 -= l4.x * x16; x26 -= l4.y * x17; x26 -= l4.z * x18; x26 -= l4.w * x19; x26 -= l5.x * x20; x26 -= l5.y * x21; x26 -= l5.z * x22; x26 -= l5.w * x23; x26 -= l6.x * x24; x26 -= l6.y * x25; } __builtin_amdgcn_sched_barrier(0);
        float x27 = GDN_RHS(27); { const v4f l0 = GDN_L4(27, 0); const v4f l1 = GDN_L4(27, 1); const v4f l2 = GDN_L4(27, 2); const v4f l3 = GDN_L4(27, 3); const v4f l4 = GDN_L4(27, 4); const v4f l5 = GDN_L4(27, 5); const v4f l6 = GDN_L4(27, 6); __builtin_amdgcn_sched_barrier(0); x27 -= l0.x * x0; x27 -= l0.y * x1; x27 -= l0.z * x2; x27 -= l0.w * x3; x27 -= l1.x * x4; x27 -= l1.y * x5; x27 -= l1.z * x6; x27 -= l1.w * x7; x27 -= l2.x * x8; x27 -= l2.y * x9; x27 -= l2.z * x10; x27 -= l2.w * x11; x27 -= l3.x * x12; x27 -= l3.y * x13; x27 -= l3.z * x14; x27 -= l3.w * x15; x27 -= l4.x * x16; x27 -= l4.y * x17; x27 -= l4.z * x18; x27 -= l4.w * x19; x27 -= l5.x * x20; x27 -= l5.y * x21; x27 -= l5.z * x22; x27 -= l5.w * x23; x27 -= l6.x * x24; x27 -= l6.y * x25; x27 -= l6.z * x26; } __builtin_amdgcn_sched_barrier(0);
        float x28 = GDN_RHS(28); { const v4f l0 = GDN_L4(28, 0); const v4f l1 = GDN_L4(28, 1); const v4f l2 = GDN_L4(28, 2); const v4f l3 = GDN_L4(28, 3); const v4f l4 = GDN_L4(28, 4); const v4f l5 = GDN_L4(28, 5); const v4f l6 = GDN_L4(28, 6); __builtin_amdgcn_sched_barrier(0); x28 -= l0.x * x0; x28 -= l0.y * x1; x28 -= l0.z * x2; x28 -= l0.w * x3; x28 -= l1.x * x4; x28 -= l1.y * x5; x28 -= l1.z * x6; x28 -= l1.w * x7; x28 -= l2.x * x8; x28 -= l2.y * x9; x28 -= l2.z * x10; x28 -= l2.w * x11; x28 -= l3.x * x12; x28 -= l3.y * x13; x28 -= l3.z * x14; x28 -= l3.w * x15; x28 -= l4.x * x16; x28 -= l4.y * x17; x28 -= l4.z * x18; x28 -= l4.w * x19; x28 -= l5.x * x20; x28 -= l5.y * x21; x28 -= l5.z * x22; x28 -= l5.w * x23; x28 -= l6.x * x24; x28 -= l6.y * x25; x28 -= l6.z * x26; x28 -= l6.w * x27; } __builtin_amdgcn_sched_barrier(0);
        float x29 = GDN_RHS(29); { const v4f l0 = GDN_L4(29, 0); const v4f l1 = GDN_L4(29, 1); const v4f l2 = GDN_L4(29, 2); const v4f l3 = GDN_L4(29, 3); const v4f l4 = GDN_L4(29, 4); const v4f l5 = GDN_L4(29, 5); const v4f l6 = GDN_L4(29, 6); const v4f l7 = GDN_L4(29, 7); __builtin_amdgcn_sched_barrier(0); x29 -= l0.x * x0; x29 -= l0.y * x1; x29 -= l0.z * x2; x29 -= l0.w * x3; x29 -= l1.x * x4; x29 -= l1.y * x5; x29 -= l1.z * x6; x29 -= l1.w * x7; x29 -= l2.x * x8; x29 -= l2.y * x9; x29 -= l2.z * x10; x29 -= l2.w * x11; x29 -= l3.x * x12; x29 -= l3.y * x13; x29 -= l3.z * x14; x29 -= l3.w * x15; x29 -= l4.x * x16; x29 -= l4.y * x17; x29 -= l4.z * x18; x29 -= l4.w * x19; x29 -= l5.x * x20; x29 -= l5.y * x21; x29 -= l5.z * x22; x29 -= l5.w * x23; x29 -= l6.x * x24; x29 -= l6.y * x25; x29 -= l6.z * x26; x29 -= l6.w * x27; x29 -= l7.x * x28; } __builtin_amdgcn_sched_barrier(0);
        float x30 = GDN_RHS(30); { const v4f l0 = GDN_L4(30, 0); const v4f l1 = GDN_L4(30, 1); const v4f l2 = GDN_L4(30, 2); const v4f l3 = GDN_L4(30, 3); const v4f l4 = GDN_L4(30, 4); const v4f l5 = GDN_L4(30, 5); const v4f l6 = GDN_L4(30, 6); const v4f l7 = GDN_L4(30, 7); __builtin_amdgcn_sched_barrier(0); x30 -= l0.x * x0; x30 -= l0.y * x1; x30 -= l0.z * x2; x30 -= l0.w * x3; x30 -= l1.x * x4; x30 -= l1.y * x5; x30 -= l1.z * x6; x30 -= l1.w * x7; x30 -= l2.x * x8; x30 -= l2.y * x9; x30 -= l2.z * x10; x30 -= l2.w * x11; x30 -= l3.x * x12; x30 -= l3.y * x13; x30 -= l3.z * x14; x30 -= l3.w * x15; x30 -= l4.x * x16; x30 -= l4.y * x17; x30 -= l4.z * x18; x30 -= l4.w * x19; x30 -= l5.x * x20; x30 -= l5.y * x21; x30 -= l5.z * x22; x30 -= l5.w * x23; x30 -= l6.x * x24; x30 -= l6.y * x25; x30 -= l6.z * x26; x30 -= l6.w * x27; x30 -= l7.x * x28; x30 -= l7.y * x29; } __builtin_amdgcn_sched_barrier(0);
        float x31 = GDN_RHS(31); { const v4f l0 = GDN_L4(31, 0); const v4f l1 = GDN_L4(31, 1); const v4f l2 = GDN_L4(31, 2); const v4f l3 = GDN_L4(31, 3); const v4f l4 = GDN_L4(31, 4); const v4f l5 = GDN_L4(31, 5); const v4f l6 = GDN_L4(31, 6); const v4f l7 = GDN_L4(31, 7); __builtin_amdgcn_sched_barrier(0); x31 -= l0.x * x0; x31 -= l0.y * x1; x31 -= l0.z * x2; x31 -= l0.w * x3; x31 -= l1.x * x4; x31 -= l1.y * x5; x31 -= l1.z * x6; x31 -= l1.w * x7; x31 -= l2.x * x8; x31 -= l2.y * x9; x31 -= l2.z * x10; x31 -= l2.w * x11; x31 -= l3.x * x12; x31 -= l3.y * x13; x31 -= l3.z * x14; x31 -= l3.w * x15; x31 -= l4.x * x16; x31 -= l4.y * x17; x31 -= l4.z * x18; x31 -= l4.w * x19; x31 -= l5.x * x20; x31 -= l5.y * x21; x31 -= l5.z * x22; x31 -= l5.w * x23; x31 -= l6.x * x24; x31 -= l6.y * x25; x31 -= l6.z * x26; x31 -= l6.w * x27; x31 -= l7.x * x28; x31 -= l7.y * x29; x31 -= l7.z * x30; } __builtin_amdgcn_sched_barrier(0);
        float x32 = GDN_RHS(32); { const v4f l0 = GDN_L4(32, 0); const v4f l1 = GDN_L4(32, 1); const v4f l2 = GDN_L4(32, 2); const v4f l3 = GDN_L4(32, 3); const v4f l4 = GDN_L4(32, 4); const v4f l5 = GDN_L4(32, 5); const v4f l6 = GDN_L4(32, 6); const v4f l7 = GDN_L4(32, 7); __builtin_amdgcn_sched_barrier(0); x32 -= l0.x * x0; x32 -= l0.y * x1; x32 -= l0.z * x2; x32 -= l0.w * x3; x32 -= l1.x * x4; x32 -= l1.y * x5; x32 -= l1.z * x6; x32 -= l1.w * x7; x32 -= l2.x * x8; x32 -= l2.y * x9; x32 -= l2.z * x10; x32 -= l2.w * x11; x32 -= l3.x * x12; x32 -= l3.y * x13; x32 -= l3.z * x14; x32 -= l3.w * x15; x32 -= l4.x * x16; x32 -= l4.y * x17; x32 -= l4.z * x18; x32 -= l4.w * x19; x32 -= l5.x * x20; x32 -= l5.y * x21; x32 -= l5.z * x22; x32 -= l5.w * x23; x32 -= l6.x * x24; x32 -= l6.y * x25; x32 -= l6.z * x26; x32 -= l6.w * x27; x32 -= l7.x * x28; x32 -= l7.y * x29; x32 -= l7.z * x30; x32 -= l7.w * x31; } __builtin_amdgcn_sched_barrier(0);
        float x33 = GDN_RHS(33); { const v4f l0 = GDN_L4(33, 0); const v4f l1 = GDN_L4(33, 1); const v4f l2 = GDN_L4(33, 2); const v4f l3 = GDN_L4(33, 3); const v4f l4 = GDN_L4(33, 4); const v4f l5 = GDN_L4(33, 5); const v4f l6 = GDN_L4(33, 6); const v4f l7 = GDN_L4(33, 7); __builtin_amdgcn_sched_barrier(0); x33 -= l0.x * x0; x33 -= l0.y * x1; x33 -= l0.z * x2; x33 -= l0.w * x3; x33 -= l1.x * x4; x33 -= l1.y * x5; x33 -= l1.z * x6; x33 -= l1.w * x7; x33 -= l2.x * x8; x33 -= l2.y * x9; x33 -= l2.z * x10; x33 -= l2.w * x11; x33 -= l3.x * x12; x33 -= l3.y * x13; x33 -= l3.z * x14; x33 -= l3.w * x15; x33 -= l4.x * x16; x33 -= l4.y * x17; x33 -= l4.z * x18; x33 -= l4.w * x19; x33 -= l5.x * x20; x33 -= l5.y * x21; x33 -= l5.z * x22; x33 -= l5.w * x23; x33 -= l6.x * x24; x33 -= l6.y * x25; x33 -= l6.z * x26; x33 -= l6.w * x27; x33 -= l7.x * x28; x33 -= l7.y * x29; x33 -= l7.z * x30; x33 -= l7.w * x31; } __builtin_amdgcn_sched_barrier(0); { const v4f l8 = GDN_L4(33, 8); __builtin_amdgcn_sched_barrier(0); x33 -= l8.x * x32; } __builtin_amdgcn_sched_barrier(0);
        float x34 = GDN_RHS(34); { const v4f l0 = GDN_L4(34, 0); const v4f l1 = GDN_L4(34, 1); const v4f l2 = GDN_L4(34, 2); const v4f l3 = GDN_L4(34, 3); const v4f l4 = GDN_L4(34, 4); const v4f l5 = GDN_L4(34, 5); const v4f l6 = GDN_L4(34, 6); const v4f l7 = GDN_L4(34, 7); __builtin_amdgcn_sched_barrier(0); x34 -= l0.x * x0; x34 -= l0.y * x1; x34 -= l0.z * x2; x34 -= l0.w * x3; x34 -= l1.x * x4; x34 -= l1.y * x5; x34 -= l1.z * x6; x34 -= l1.w * x7; x34 -= l2.x * x8; x34 -= l2.y * x9; x34 -= l2.z * x10; x34 -= l2.w * x11; x34 -= l3.x * x12; x34 -= l3.y * x13; x34 -= l3.z * x14; x34 -= l3.w * x15; x34 -= l4.x * x16; x34 -= l4.y * x17; x34 -= l4.z * x18; x34 -= l4.w * x19; x34 -= l5.x * x20; x34 -= l5.y * x21; x34 -= l5.z * x22; x34 -= l5.w * x23; x34 -= l6.x * x24; x34 -= l6.y * x25; x34 -= l6.z * x26; x34 -= l6.w * x27; x34 -= l7.x * x28; x34 -= l7.y * x29; x34 -= l7.z * x30; x34 -= l7.w * x31; } __builtin_amdgcn_sched_barrier(0); { const v4f l8 = GDN_L4(34, 8); __builtin_amdgcn_sched_barrier(0); x34 -= l8.x * x32; x34 -= l8.y * x33; } __builtin_amdgcn_sched_barrier(0);
        float x35 = GDN_RHS(35); { const v4f l0 = GDN_L4(35, 0); const v4f l1 = GDN_L4(35, 1); const v4f l2 = GDN_L4(35, 2); const v4f l3 = GDN_L4(35, 3); const v4f l4 = GDN_L4(35, 4); const v4f l5 = GDN_L4(35, 5); const v4f l6 = GDN_L4(35, 6); const v4f l7 = GDN_L4(35, 7); __builtin_amdgcn_sched_barrier(0); x35 -= l0.x * x0; x35 -= l0.y * x1; x35 -= l0.z * x2; x35 -= l0.w * x3; x35 -= l1.x * x4; x35 -= l1.y * x5; x35 -= l1.z * x6; x35 -= l1.w * x7; x35 -= l2.x * x8; x35 -= l2.y * x9; x35 -= l2.z * x10; x35 -= l2.w * x11; x35 -= l3.x * x12; x35 -= l3.y * x13; x35 -= l3.z * x14; x35 -= l3.w * x15; x35 -= l4.x * x16; x35 -= l4.y * x17; x35 -= l4.z * x18; x35 -= l4.w * x19; x35 -= l5.x * x20; x35 -= l5.y * x21; x35 -= l5.z * x22; x35 -= l5.w * x23; x35 -= l6.x * x24; x35 -= l6.y * x25; x35 -= l6.z * x26; x35 -= l6.w * x27; x35 -= l7.x * x28; x35 -= l7.y * x29; x35 -= l7.z * x30; x35 -= l7.w * x31; } __builtin_amdgcn_sched_barrier(0); { const v4f l8 = GDN_L4(35, 8); __builtin_amdgcn_sched_barrier(0); x35 -= l8.x * x32; x35 -= l8.y * x33; x35 -= l8.z * x34; } __builtin_amdgcn_sched_barrier(0);
        float x36 = GDN_RHS(36); { const v4f l0 = GDN_L4(36, 0); const v4f l1 = GDN_L4(36, 1); const v4f l2 = GDN_L4(36, 2); const v4f l3 = GDN_L4(36, 3); const v4f l4 = GDN_L4(36, 4); const v4f l5 = GDN_L4(36, 5); const v4f l6 = GDN_L4(36, 6); const v4f l7 = GDN_L4(36, 7); __builtin_amdgcn_sched_barrier(0); x36 -= l0.x * x0; x36 -= l0.y * x1; x36 -= l0.z * x2; x36 -= l0.w * x3; x36 -= l1.x * x4; x36 -= l1.y * x5; x36 -= l1.z * x6; x36 -= l1.w * x7; x36 -= l2.x * x8; x36 -= l2.y * x9; x36 -= l2.z * x10; x36 -= l2.w * x11; x36 -= l3.x * x12; x36 -= l3.y * x13; x36 -= l3.z * x14; x36 -= l3.w * x15; x36 -= l4.x * x16; x36 -= l4.y * x17; x36 -= l4.z * x18; x36 -= l4.w * x19; x36 -= l5.x * x20; x36 -= l5.y * x21; x36 -= l5.z * x22; x36 -= l5.w * x23; x36 -= l6.x * x24; x36 -= l6.y * x25; x36 -= l6.z * x26; x36 -= l6.w * x27; x36 -= l7.x * x28; x36 -= l7.y * x29; x36 -= l7.z * x30; x36 -= l7.w * x31; } __builtin_amdgcn_sched_barrier(0); { const v4f l8 = GDN_L4(36, 8); __builtin_amdgcn_sched_barrier(0); x36 -= l8.x * x32; x36 -= l8.y * x33; x36 -= l8.z * x34; x36 -= l8.w * x35; } __builtin_amdgcn_sched_barrier(0);
        float x37 = GDN_RHS(37); { const v4f l0 = GDN_L4(37, 0); const v4f l1 = GDN_L4(37, 1); const v4f l2 = GDN_L4(37, 2); const v4f l3 = GDN_L4(37, 3); const v4f l4 = GDN_L4(37, 4); const v4f l5 = GDN_L4(37, 5); const v4f l6 = GDN_L4(37, 6); const v4f l7 = GDN_L4(37, 7); __builtin_amdgcn_sched_barrier(0); x37 -= l0.x * x0; x37 -= l0.y * x1; x37 -= l0.z * x2; x37 -= l0.w * x3; x37 -= l1.x * x4; x37 -= l1.y * x5; x37 -= l1.z * x6; x37 -= l1.w * x7; x37 -= l2.x * x8; x37 -= l2.y * x9; x37 -= l2.z * x10; x37 -= l2.w * x11; x37 -= l3.x * x12; x37 -= l3.y * x13; x37 -= l3.z * x14; x37 -= l3.w * x15; x37 -= l4.x * x16; x37 -= l4.y * x17; x37 -= l4.z * x18; x37 -= l4.w * x19; x37 -= l5.x * x20; x37 -= l5.y * x21; x37 -= l5.z * x22; x37 -= l5.w * x23; x37 -= l6.x * x24; x37 -= l6.y * x25; x37 -= l6.z * x26; x37 -= l6.w * x27; x37 -= l7.x * x28; x37 -= l7.y * x29; x37 -= l7.z * x30; x37 -= l7.w * x31; } __builtin_amdgcn_sched_barrier(0); { const v4f l8 = GDN_L4(37, 8); const v4f l9 = GDN_L4(37, 9); __builtin_amdgcn_sched_barrier(0); x37 -= l8.x * x32; x37 -= l8.y * x33; x37 -= l8.z * x34; x37 -= l8.w * x35; x37 -= l9.x * x36; } __builtin_amdgcn_sched_barrier(0);
        float x38 = GDN_RHS(38); { const v4f l0 = GDN_L4(38, 0); const v4f l1 = GDN_L4(38, 1); const v4f l2 = GDN_L4(38, 2); const v4f l3 = GDN_L4(38, 3); const v4f l4 = GDN_L4(38, 4); const v4f l5 = GDN_L4(38, 5); const v4f l6 = GDN_L4(38, 6); const v4f l7 = GDN_L4(38, 7); __builtin_amdgcn_sched_barrier(0); x38 -= l0.x * x0; x38 -= l0.y * x1; x38 -= l0.z * x2; x38 -= l0.w * x3; x38 -= l1.x * x4; x38 -= l1.y * x5; x38 -= l1.z * x6; x38 -= l1.w * x7; x38 -= l2.x * x8; x38 -= l2.y * x9; x38 -= l2.z * x10; x38 -= l2.w * x11; x38 -= l3.x * x12; x38 -= l3.y * x13; x38 -= l3.z * x14; x38 -= l3.w * x15; x38 -= l4.x * x16; x38 -= l4.y * x17; x38 -= l4.z * x18; x38 -= l4.w * x19; x38 -= l5.x * x20; x38 -= l5.y * x21; x38 -= l5.z * x22; x38 -= l5.w * x23; x38 -= l6.x * x24; x38 -= l6.y * x25; x38 -= l6.z * x26; x38 -= l6.w * x27; x38 -= l7.x * x28; x38 -= l7.y * x29; x38 -= l7.z * x30; x38 -= l7.w * x31; } __builtin_amdgcn_sched_barrier(0); { const v4f l8 = GDN_L4(38, 8); const v4f l9 = GDN_L4(38, 9); __builtin_amdgcn_sched_barrier(0); x38 -= l8.x * x32; x38 -= l8.y * x33; x38 -= l8.z * x34; x38 -= l8.w * x35; x38 -= l9.x * x36; x38 -= l9.y * x37; } __builtin_amdgcn_sched_barrier(0);
        float x39 = GDN_RHS(39); { const v4f l0 = GDN_L4(39, 0); const v4f l1 = GDN_L4(39, 1); const v4f l2 = GDN_L4(39, 2); const v4f l3 = GDN_L4(39, 3); const v4f l4 = GDN_L4(39, 4); const v4f l5 = GDN_L4(39, 5); const v4f l6 = GDN_L4(39, 6); const v4f l7 = GDN_L4(39, 7); __builtin_amdgcn_sched_barrier(0); x39 -= l0.x * x0; x39 -= l0.y * x1; x39 -= l0.z * x2; x39 -= l0.w * x3; x39 -= l1.x * x4; x39 -= l1.y * x5; x39 -= l1.z * x6; x39 -= l1.w * x7; x39 -= l2.x * x8; x39 -= l2.y * x9; x39 -= l2.z * x10; x39 -= l2.w * x11; x39 -= l3.x * x12; x39 -= l3.y * x13; x39 -= l3.z * x14; x39 -= l3.w * x15; x39 -= l4.x * x16; x39 -= l4.y * x17; x39 -= l4.z * x18; x39 -= l4.w * x19; x39 -= l5.x * x20; x39 -= l5.y * x21; x39 -= l5.z * x22; x39 -= l5.w * x23; x39 -= l6.x * x24; x39 -= l6.y * x25; x39 -= l6.z * x26; x39 -= l6.w * x27; x39 -= l7.x * x28; x39 -= l7.y * x29; x39 -= l7.z * x30; x39 -= l7.w * x31; } __builtin_amdgcn_sched_barrier(0); { const v4f l8 = GDN_L4(39, 8); const v4f l9 = GDN_L4(39, 9); __builtin_amdgcn_sched_barrier(0); x39 -= l8.x * x32; x39 -= l8.y * x33; x39 -= l8.z * x34; x39 -= l8.w * x35; x39 -= l9.x * x36; x39 -= l9.y * x37; x39 -= l9.z * x38; } __builtin_amdgcn_sched_barrier(0);
        float x40 = GDN_RHS(40); { const v4f l0 = GDN_L4(40, 0); const v4f l1 = GDN_L4(40, 1); const v4f l2 = GDN_L4(40, 2); const v4f l3 = GDN_L4(40, 3); const v4f l4 = GDN_L4(40, 4); const v4f l5 = GDN_L4(40, 5); const v4f l6 = GDN_L4(40, 6); const v4f l7 = GDN_L4(40, 7); __builtin_amdgcn_sched_barrier(0); x40 -= l0.x * x0; x40 -= l0.y * x1; x40 -= l0.z * x2; x40 -= l0.w * x3; x40 -= l1.x * x4; x40 -= l1.y * x5; x40 -= l1.z * x6; x40 -= l1.w * x7; x40 -= l2.x * x8; x40 -= l2.y * x9; x40 -= l2.z * x10; x40 -= l2.w * x11; x40 -= l3.x * x12; x40 -= l3.y * x13; x40 -= l3.z * x14; x40 -= l3.w * x15; x40 -= l4.x * x16; x40 -= l4.y * x17; x40 -= l4.z * x18; x40 -= l4.w * x19; x40 -= l5.x * x20; x40 -= l5.y * x21; x40 -= l5.z * x22; x40 -= l5.w * x23; x40 -= l6.x * x24; x40 -= l6.y * x25; x40 -= l6.z * x26; x40 -= l6.w * x27; x40 -= l7.x * x28; x40 -= l7.y * x29; x40 -= l7.z * x30; x40 -= l7.w * x31; } __builtin_amdgcn_sched_barrier(0); { const v4f l8 = GDN_L4(40, 8); const v4f l9 = GDN_L4(40, 9); __builtin_amdgcn_sched_barrier(0); x40 -= l8.x * x32; x40 -= l8.y * x33; x40 -= l8.z * x34; x40 -= l8.w * x35; x40 -= l9.x * x36; x40 -= l9.y * x37; x40 -= l9.z * x38; x40 -= l9.w * x39; } __builtin_amdgcn_sched_barrier(0);
        float x41 = GDN_RHS(41); { const v4f l0 = GDN_L4(41, 0); const v4f l1 = GDN_L4(41, 1); const v4f l2 = GDN_L4(41, 2); const v4f l3 = GDN_L4(41, 3); const v4f l4 = GDN_L4(41, 4); const v4f l5 = GDN_L4(41, 5); const v4f l6 = GDN_L4(41, 6); const v4f l7 = GDN_L4(41, 7); __builtin_amdgcn_sched_barrier(0); x41 -= l0.x * x0; x41 -= l0.y * x1; x41 -= l0.z * x2; x41 -= l0.w * x3; x41 -= l1.x * x4; x41 -= l1.y * x5; x41 -= l1.z * x6; x41 -= l1.w * x7; x41 -= l2.x * x8; x41 -= l2.y * x9; x41 -= l2.z * x10; x41 -= l2.w * x11; x41 -= l3.x * x12; x41 -= l3.y * x13; x41 -= l3.z * x14; x41 -= l3.w * x15; x41 -= l4.x * x16; x41 -= l4.y * x17; x41 -= l4.z * x18; x41 -= l4.w * x19; x41 -= l5.x * x20; x41 -= l5.y * x21; x41 -= l5.z * x22; x41 -= l5.w * x23; x41 -= l6.x * x24; x41 -= l6.y * x25; x41 -= l6.z * x26; x41 -= l6.w * x27; x41 -= l7.x * x28; x41 -= l7.y * x29; x41 -= l7.z * x30; x41 -= l7.w * x31; } __builtin_amdgcn_sched_barrier(0); { const v4f l8 = GDN_L4(41, 8); const v4f l9 = GDN_L4(41, 9); const v4f l10 = GDN_L4(41, 10); __builtin_amdgcn_sched_barrier(0); x41 -= l8.x * x32; x41 -= l8.y * x33; x41 -= l8.z * x34; x41 -= l8.w * x35; x41 -= l9.x * x36; x41 -= l9.y * x37; x41 -= l9.z * x38; x41 -= l9.w * x39; x41 -= l10.x * x40; } __builtin_amdgcn_sched_barrier(0);
        float x42 = GDN_RHS(42); { const v4f l0 = GDN_L4(42, 0); const v4f l1 = GDN_L4(42, 1); const v4f l2 = GDN_L4(42, 2); const v4f l3 = GDN_L4(42, 3); const v4f l4 = GDN_L4(42, 4); const v4f l5 = GDN_L4(42, 5); const v4f l6 = GDN_L4(42, 6); const v4f l7 = GDN_L4(42, 7); __builtin_amdgcn_sched_barrier(0); x42 -= l0.x * x0; x42 -= l0.y * x1; x42 -= l0.z * x2; x42 -= l0.w * x3; x42 -= l1.x * x4; x42 -= l1.y * x5; x42 -= l1.z * x6; x42 -= l1.w * x7; x42 -= l2.x * x8; x42 -= l2.y * x9; x42 -= l2.z * x10; x42 -= l2.w * x11; x42 -= l3.x * x12; x42 -= l3.y * x13; x42 -= l3.z * x14; x42 -= l3.w * x15; x42 -= l4.x * x16; x42 -= l4.y * x17; x42 -= l4.z * x18; x42 -= l4.w * x19; x42 -= l5.x * x20; x42 -= l5.y * x21; x42 -= l5.z * x22; x42 -= l5.w * x23; x42 -= l6.x * x24; x42 -= l6.y * x25; x42 -= l6.z * x26; x42 -= l6.w * x27; x42 -= l7.x * x28; x42 -= l7.y * x29; x42 -= l7.z * x30; x42 -= l7.w * x31; } __builtin_amdgcn_sched_barrier(0); { const v4f l8 = GDN_L4(42, 8); const v4f l9 = GDN_L4(42, 9); const v4f l10 = GDN_L4(42, 10); __builtin_amdgcn_sched_barrier(0); x42 -= l8.x * x32; x42 -= l8.y * x33; x42 -= l8.z * x34; x42 -= l8.w * x35; x42 -= l9.x * x36; x42 -= l9.y * x37; x42 -= l9.z * x38; x42 -= l9.w * x39; x42 -= l10.x * x40; x42 -= l10.y * x41; } __builtin_amdgcn_sched_barrier(0);
        float x43 = GDN_RHS(43); { const v4f l0 = GDN_L4(43, 0); const v4f l1 = GDN_L4(43, 1); const v4f l2 = GDN_L4(43, 2); const v4f l3 = GDN_L4(43, 3); const v4f l4 = GDN_L4(43, 4); const v4f l5 = GDN_L4(43, 5); const v4f l6 = GDN_L4(43, 6); const v4f l7 = GDN_L4(43, 7); __builtin_amdgcn_sched_barrier(0); x43 -= l0.x * x0; x43 -= l0.y * x1; x43 -= l0.z * x2; x43 -= l0.w * x3; x43 -= l1.x * x4; x43 -= l1.y * x5; x43 -= l1.z * x6; x43 -= l1.w * x7; x43 -= l2.x * x8; x43 -= l2.y * x9; x43 -= l2.z * x10; x43 -= l2.w * x11; x43 -= l3.x * x12; x43 -= l3.y * x13; x43 -= l3.z * x14; x43 -= l3.w * x15; x43 -= l4.x * x16; x43 -= l4.y * x17; x43 -= l4.z * x18; x43 -= l4.w * x19; x43 -= l5.x * x20; x43 -= l5.y * x21; x43 -= l5.z * x22; x43 -= l5.w * x23; x43 -= l6.x * x24; x43 -= l6.y * x25; x43 -= l6.z * x26; x43 -= l6.w * x27; x43 -= l7.x * x28; x43 -= l7.y * x29; x43 -= l7.z * x30; x43 -= l7.w * x31; } __builtin_amdgcn_sched_barrier(0); { const v4f l8 = GDN_L4(43, 8); const v4f l9 = GDN_L4(43, 9); const v4f l10 = GDN_L4(43, 10); __builtin_amdgcn_sched_barrier(0); x43 -= l8.x * x32; x43 -= l8.y * x33; x43 -= l8.z * x34; x43 -= l8.w * x35; x43 -= l9.x * x36; x43 -= l9.y * x37; x43 -= l9.z * x38; x43 -= l9.w * x39; x43 -= l10.x * x40; x43 -= l10.y * x41; x43 -= l10.z * x42; } __builtin_amdgcn_sched_barrier(0);
        float x44 = GDN_RHS(44); { const v4f l0 = GDN_L4(44, 0); const v4f l1 = GDN_L4(44, 1); const v4f l2 = GDN_L4(44, 2); const v4f l3 = GDN_L4(44, 3); const v4f l4 = GDN_L4(44, 4); const v4f l5 = GDN_L4(44, 5); const v4f l6 = GDN_L4(44, 6); const v4f l7 = GDN_L4(44, 7); __builtin_amdgcn_sched_barrier(0); x44 -= l0.x * x0; x44 -= l0.y * x1; x44 -= l0.z * x2; x44 -= l0.w * x3; x44 -= l1.x * x4; x44 -= l1.y * x5; x44 -= l1.z * x6; x44 -= l1.w * x7; x44 -= l2.x * x8; x44 -= l2.y * x9; x44 -= l2.z * x10; x44 -= l2.w * x11; x44 -= l3.x * x12; x44 -= l3.y * x13; x44 -= l3.z * x14; x44 -= l3.w * x15; x44 -= l4.x * x16; x44 -= l4.y * x17; x44 -= l4.z * x18; x44 -= l4.w * x19; x44 -= l5.x * x20; x44 -= l5.y * x21; x44 -= l5.z * x22; x44 -= l5.w * x23; x44 -= l6.x * x24; x44 -= l6.y * x25; x44 -= l6.z * x26; x44 -= l6.w * x27; x44 -= l7.x * x28; x44 -= l7.y * x29; x44 -= l7.z * x30; x44 -= l7.w * x31; } __builtin_amdgcn_sched_barrier(0); { const v4f l8 = GDN_L4(44, 8); const v4f l9 = GDN_L4(44, 9); const v4f l10 = GDN_L4(44, 10); __builtin_amdgcn_sched_barrier(0); x44 -= l8.x * x32; x44 -= l8.y * x33; x44 -= l8.z * x34; x44 -= l8.w * x35; x44 -= l9.x * x36; x44 -= l9.y * x37; x44 -= l9.z * x38; x44 -= l9.w * x39; x44 -= l10.x * x40; x44 -= l10.y * x41; x44 -= l10.z * x42; x44 -= l10.w * x43; } __builtin_amdgcn_sched_barrier(0);
        float x45 = GDN_RHS(45); { const v4f l0 = GDN_L4(45, 0); const v4f l1 = GDN_L4(45, 1); const v4f l2 = GDN_L4(45, 2); const v4f l3 = GDN_L4(45, 3); const v4f l4 = GDN_L4(45, 4); const v4f l5 = GDN_L4(45, 5); const v4f l6 = GDN_L4(45, 6); const v4f l7 = GDN_L4(45, 7); __builtin_amdgcn_sched_barrier(0); x45 -= l0.x * x0; x45 -= l0.y * x1; x45 -= l0.z * x2; x45 -= l0.w * x3; x45 -= l1.x * x4; x45 -= l1.y * x5; x45 -= l1.z * x6; x45 -= l1.w * x7; x45 -= l2.x * x8; x45 -= l2.y * x9; x45 -= l2.z * x10; x45 -= l2.w * x11; x45 -= l3.x * x12; x45 -= l3.y * x13; x45 -= l3.z * x14; x45 -= l3.w * x15; x45 -= l4.x * x16; x45 -= l4.y * x17; x45 -= l4.z * x18; x45 -= l4.w * x19; x45 -= l5.x * x20; x45 -= l5.y * x21; x45 -= l5.z * x22; x45 -= l5.w * x23; x45 -= l6.x * x24; x45 -= l6.y * x25; x45 -= l6.z * x26; x45 -= l6.w * x27; x45 -= l7.x * x28; x45 -= l7.y * x29; x45 -= l7.z * x30; x45 -= l7.w * x31; } __builtin_amdgcn_sched_barrier(0); { const v4f l8 = GDN_L4(45, 8); const v4f l9 = GDN_L4(45, 9); const v4f l10 = GDN_L4(45, 10); const v4f l11 = GDN_L4(45, 11); __builtin_amdgcn_sched_barrier(0); x45 -= l8.x * x32; x45 -= l8.y * x33; x45 -= l8.z * x34; x45 -= l8.w * x35; x45 -= l9.x * x36; x45 -= l9.y * x37; x45 -= l9.z * x38; x45 -= l9.w * x39; x45 -= l10.x * x40; x45 -= l10.y * x41; x45 -= l10.z * x42; x45 -= l10.w * x43; x45 -= l11.x * x44; } __builtin_amdgcn_sched_barrier(0);
        float x46 = GDN_RHS(46); { const v4f l0 = GDN_L4(46, 0); const v4f l1 = GDN_L4(46, 1); const v4f l2 = GDN_L4(46, 2); const v4f l3 = GDN_L4(46, 3); const v4f l4 = GDN_L4(46, 4); const v4f l5 = GDN_L4(46, 5); const v4f l6 = GDN_L4(46, 6); const v4f l7 = GDN_L4(46, 7); __builtin_amdgcn_sched_barrier(0); x46 -= l0.x * x0; x46 -= l0.y * x1; x46 -= l0.z * x2; x46 -= l0.w * x3; x46 -= l1.x * x4; x46 -= l1.y * x5; x46 -= l1.z * x6; x46 -= l1.w * x7; x46 -= l2.x * x8; x46 -= l2.y * x9; x46 -= l2.z * x10; x46 -= l2.w * x11; x46 -= l3.x * x12; x46 -= l3.y * x13; x46 -= l3.z * x14; x46 -= l3.w * x15; x46 -= l4.x * x16; x46 -= l4.y * x17; x46 -= l4.z * x18; x46 -= l4.w * x19; x46 -= l5.x * x20; x46 -= l5.y * x21; x46 -= l5.z * x22; x46 -= l5.w * x23; x46 -= l6.x * x24; x46 -= l6.y * x25; x46 -= l6.z * x26; x46 -= l6.w * x27; x46 -= l7.x * x28; x46 -= l7.y * x29; x46 -= l7.z * x30; x46 -= l7.w * x31; } __builtin_amdgcn_sched_barrier(0); { const v4f l8 = GDN_L4(46, 8); const v4f l9 = GDN_L4(46, 9); const v4f l10 = GDN_L4(46, 10); const v4f l11 = GDN_L4(46, 11); __builtin_amdgcn_sched_barrier(0); x46 -= l8.x * x32; x46 -= l8.y * x33; x46 -= l8.z * x34; x46 -= l8.w * x35; x46 -= l9.x * x36; x46 -= l9.y * x37; x46 -= l9.z * x38; x46 -= l9.w * x39; x46 -= l10.x * x40; x46 -= l10.y * x41; x46 -= l10.z * x42; x46 -= l10.w * x43; x46 -= l11.x * x44; x46 -= l11.y * x45; } __builtin_amdgcn_sched_barrier(0);
        float x47 = GDN_RHS(47); { const v4f l0 = GDN_L4(47, 0); const v4f l1 = GDN_L4(47, 1); const v4f l2 = GDN_L4(47, 2); const v4f l3 = GDN_L4(47, 3); const v4f l4 = GDN_L4(47, 4); const v4f l5 = GDN_L4(47, 5); const v4f l6 = GDN_L4(47, 6); const v4f l7 = GDN_L4(47, 7); __builtin_amdgcn_sched_barrier(0); x47 -= l0.x * x0; x47 -= l0.y * x1; x47 -= l0.z * x2; x47 -= l0.w * x3; x47 -= l1.x * x4; x47 -= l1.y * x5; x47 -= l1.z * x6; x47 -= l1.w * x7; x47 -= l2.x * x8; x47 -= l2.y * x9; x47 -= l2.z * x10; x47 -= l2.w * x11; x47 -= l3.x * x12; x47 -= l3.y * x13; x47 -= l3.z * x14; x47 -= l3.w * x15; x47 -= l4.x * x16; x47 -= l4.y * x17; x47 -= l4.z * x18; x47 -= l4.w * x19; x47 -= l5.x * x20; x47 -= l5.y * x21; x47 -= l5.z * x22; x47 -= l5.w * x23; x47 -= l6.x * x24; x47 -= l6.y * x25; x47 -= l6.z * x26; x47 -= l6.w * x27; x47 -= l7.x * x28; x47 -= l7.y * x29; x47 -= l7.z * x30; x47 -= l7.w * x31; } __builtin_amdgcn_sched_barrier(0); { const v4f l8 = GDN_L4(47, 8); const v4f l9 = GDN_L4(47, 9); const v4f l10 = GDN_L4(47, 10); const v4f l11 = GDN_L4(47, 11); __builtin_amdgcn_sched_barrier(0); x47 -= l8.x * x32; x47 -= l8.y * x33; x47 -= l8.z * x34; x47 -= l8.w * x35; x47 -= l9.x * x36; x47 -= l9.y * x37; x47 -= l9.z * x38; x47 -= l9.w * x39; x47 -= l10.x * x40; x47 -= l10.y * x41; x47 -= l10.z * x42; x47 -= l10.w * x43; x47 -= l11.x * x44; x47 -= l11.y * x45; x47 -= l11.z * x46; } __builtin_amdgcn_sched_barrier(0);
        float x48 = GDN_RHS(48); { const v4f l0 = GDN_L4(48, 0); const v4f l1 = GDN_L4(48, 1); const v4f l2 = GDN_L4(48, 2); const v4f l3 = GDN_L4(48, 3); const v4f l4 = GDN_L4(48, 4); const v4f l5 = GDN_L4(48, 5); const v4f l6 = GDN_L4(48, 6); const v4f l7 = GDN_L4(48, 7); __builtin_amdgcn_sched_barrier(0); x48 -= l0.x * x0; x48 -= l0.y * x1; x48 -= l0.z * x2; x48 -= l0.w * x3; x48 -= l1.x * x4; x48 -= l1.y * x5; x48 -= l1.z * x6; x48 -= l1.w * x7; x48 -= l2.x * x8; x48 -= l2.y * x9; x48 -= l2.z * x10; x48 -= l2.w * x11; x48 -= l3.x * x12; x48 -= l3.y * x13; x48 -= l3.z * x14; x48 -= l3.w * x15; x48 -= l4.x * x16; x48 -= l4.y * x17; x48 -= l4.z * x18; x48 -= l4.w * x19; x48 -= l5.x * x20; x48 -= l5.y * x21; x48 -= l5.z * x22; x48 -= l5.w * x23; x48 -= l6.x * x24; x48 -= l6.y * x25; x48 -= l6.z * x26; x48 -= l6.w * x27; x48 -= l7.x * x28; x48 -= l7.y * x29; x48 -= l7.z * x30; x48 -= l7.w * x31; } __builtin_amdgcn_sched_barrier(0); { const v4f l8 = GDN_L4(48, 8); const v4f l9 = GDN_L4(48, 9); const v4f l10 = GDN_L4(48, 10); const v4f l11 = GDN_L4(48, 11); __builtin_amdgcn_sched_barrier(0); x48 -= l8.x * x32; x48 -= l8.y * x33; x48 -= l8.z * x34; x48 -= l8.w * x35; x48 -= l9.x * x36; x48 -= l9.y * x37; x48 -= l9.z * x38; x48 -= l9.w * x39; x48 -= l10.x * x40; x48 -= l10.y * x41; x48 -= l10.z * x42; x48 -= l10.w * x43; x48 -= l11.x * x44; x48 -= l11.y * x45; x48 -= l11.z * x46; x48 -= l11.w * x47; } __builtin_amdgcn_sched_barrier(0);
        float x49 = GDN_RHS(49); { const v4f l0 = GDN_L4(49, 0); const v4f l1 = GDN_L4(49, 1); const v4f l2 = GDN_L4(49, 2); const v4f l3 = GDN_L4(49, 3); const v4f l4 = GDN_L4(49, 4); const v4f l5 = GDN_L4(49, 5); const v4f l6 = GDN_L4(49, 6); const v4f l7 = GDN_L4(49, 7); __builtin_amdgcn_sched_barrier(0); x49 -= l0.x * x0; x49 -= l0.y * x1; x49 -= l0.z * x2; x49 -= l0.w * x3; x49 -= l1.x * x4; x49 -= l1.y * x5; x49 -= l1.z * x6; x49 -= l1.w * x7; x49 -= l2.x * x8; x49 -= l2.y * x9; x49 -= l2.z * x10; x49 -= l2.w * x11; x49 -= l3.x * x12; x49 -= l3.y * x13; x49 -= l3.z * x14; x49 -= l3.w * x15; x49 -= l4.x * x16; x49 -= l4.y * x17; x49 -= l4.z * x18; x49 -= l4.w * x19; x49 -= l5.x * x20; x49 -= l5.y * x21; x49 -= l5.z * x22; x49 -= l5.w * x23; x49 -= l6.x * x24; x49 -= l6.y * x25; x49 -= l6.z * x26; x49 -= l6.w * x27; x49 -= l7.x * x28; x49 -= l7.y * x29; x49 -= l7.z * x30; x49 -= l7.w * x31; } __builtin_amdgcn_sched_barrier(0); { const v4f l8 = GDN_L4(49, 8); const v4f l9 = GDN_L4(49, 9); const v4f l10 = GDN_L4(49, 10); const v4f l11 = GDN_L4(49, 11); const v4f l12 = GDN_L4(49, 12); __builtin_amdgcn_sched_barrier(0); x49 -= l8.x * x32; x49 -= l8.y * x33; x49 -= l8.z * x34; x49 -= l8.w * x35; x49 -= l9.x * x36; x49 -= l9.y * x37; x49 -= l9.z * x38; x49 -= l9.w * x39; x49 -= l10.x * x40; x49 -= l10.y * x41; x49 -= l10.z * x42; x49 -= l10.w * x43; x49 -= l11.x * x44; x49 -= l11.y * x45; x49 -= l11.z * x46; x49 -= l11.w * x47; x49 -= l12.x * x48; } __builtin_amdgcn_sched_barrier(0);
        float x50 = GDN_RHS(50); { const v4f l0 = GDN_L4(50, 0); const v4f l1 = GDN_L4(50, 1); const v4f l2 = GDN_L4(50, 2); const v4f l3 = GDN_L4(50, 3); const v4f l4 = GDN_L4(50, 4); const v4f l5 = GDN_L4(50, 5); const v4f l6 = GDN_L4(50, 6); const v4f l7 = GDN_L4(50, 7); __builtin_amdgcn_sched_barrier(0); x50 -= l0.x * x0; x50 -= l0.y * x1; x50 -= l0.z * x2; x50 -= l0.w * x3; x50 -= l1.x * x4; x50 -= l1.y * x5; x50 -= l1.z * x6; x50 -= l1.w * x7; x50 -= l2.x * x8; x50 -= l2.y * x9; x50 -= l2.z * x10; x50 -= l2.w * x11; x50 -= l3.x * x12; x50 -= l3.y * x13; x50 -= l3.z * x14; x50 -= l3.w * x15; x50 -= l4.x * x16; x50 -= l4.y * x17; x50 -= l4.z * x18; x50 -= l4.w * x19; x50 -= l5.x * x20; x50 -= l5.y * x21; x50 -= l5.z * x22; x50 -= l5.w * x23; x50 -= l6.x * x24; x50 -= l6.y * x25; x50 -= l6.z * x26; x50 -= l6.w * x27; x50 -= l7.x * x28; x50 -= l7.y * x29; x50 -= l7.z * x30; x50 -= l7.w * x31; } __builtin_amdgcn_sched_barrier(0); { const v4f l8 = GDN_L4(50, 8); const v4f l9 = GDN_L4(50, 9); const v4f l10 = GDN_L4(50, 10); const v4f l11 = GDN_L4(50, 11); const v4f l12 = GDN_L4(50, 12); __builtin_amdgcn_sched_barrier(0); x50 -= l8.x * x32; x50 -= l8.y * x33; x50 -= l8.z * x34; x50 -= l8.w * x35; x50 -= l9.x * x36; x50 -= l9.y * x37; x50 -= l9.z * x38; x50 -= l9.w * x39; x50 -= l10.x * x40; x50 -= l10.y * x41; x50 -= l10.z * x42; x50 -= l10.w * x43; x50 -= l11.x * x44; x50 -= l11.y * x45; x50 -= l11.z * x46; x50 -= l11.w * x47; x50 -= l12.x * x48; x50 -= l12.y * x49; } __builtin_amdgcn_sched_barrier(0);
        float x51 = GDN_RHS(51); { const v4f l0 = GDN_L4(51, 0); const v4f l1 = GDN_L4(51, 1); const v4f l2 = GDN_L4(51, 2); const v4f l3 = GDN_L4(51, 3); const v4f l4 = GDN_L4(51, 4); const v4f l5 = GDN_L4(51, 5); const v4f l6 = GDN_L4(51, 6); const v4f l7 = GDN_L4(51, 7); __builtin_amdgcn_sched_barrier(0); x51 -= l0.x * x0; x51 -= l0.y * x1; x51 -= l0.z * x2; x51 -= l0.w * x3; x51 -= l1.x * x4; x51 -= l1.y * x5; x51 -= l1.z * x6; x51 -= l1.w * x7; x51 -= l2.x * x8; x51 -= l2.y * x9; x51 -= l2.z * x10; x51 -= l2.w * x11; x51 -= l3.x * x12; x51 -= l3.y * x13; x51 -= l3.z * x14; x51 -= l3.w * x15; x51 -= l4.x * x16; x51 -= l4.y * x17; x51 -= l4.z * x18; x51 -= l4.w * x19; x51 -= l5.x * x20; x51 -= l5.y * x21; x51 -= l5.z * x22; x51 -= l5.w * x23; x51 -= l6.x * x24; x51 -= l6.y * x25; x51 -= l6.z * x26; x51 -= l6.w * x27; x51 -= l7.x * x28; x51 -= l7.y * x29; x51 -= l7.z * x30; x51 -= l7.w * x31; } __builtin_amdgcn_sched_barrier(0); { const v4f l8 = GDN_L4(51, 8); const v4f l9 = GDN_L4(51, 9); const v4f l10 = GDN_L4(51, 10); const v4f l11 = GDN_L4(51, 11); const v4f l12 = GDN_L4(51, 12); __builtin_amdgcn_sched_barrier(0); x51 -= l8.x * x32; x51 -= l8.y * x33; x51 -= l8.z * x34; x51 -= l8.w * x35; x51 -= l9.x * x36; x51 -= l9.y * x37; x51 -= l9.z * x38; x51 -= l9.w * x39; x51 -= l10.x * x40; x51 -= l10.y * x41; x51 -= l10.z * x42; x51 -= l10.w * x43; x51 -= l11.x * x44; x51 -= l11.y * x45; x51 -= l11.z * x46; x51 -= l11.w * x47; x51 -= l12.x * x48; x51 -= l12.y * x49; x51 -= l12.z * x50; } __builtin_amdgcn_sched_barrier(0);
        float x52 = GDN_RHS(52); { const v4f l0 = GDN_L4(52, 0); const v4f l1 = GDN_L4(52, 1); const v4f l2 = GDN_L4(52, 2); const v4f l3 = GDN_L4(52, 3); const v4f l4 = GDN_L4(52, 4); const v4f l5 = GDN_L4(52, 5); const v4f l6 = GDN_L4(52, 6); const v4f l7 = GDN_L4(52, 7); __builtin_amdgcn_sched_barrier(0); x52 -= l0.x * x0; x52 -= l0.y * x1; x52 -= l0.z * x2; x52 -= l0.w * x3; x52 -= l1.x * x4; x52 -= l1.y * x5; x52 -= l1.z * x6; x52 -= l1.w * x7; x52 -= l2.x * x8; x52 -= l2.y * x9; x52 -= l2.z * x10; x52 -= l2.w * x11; x52 -= l3.x * x12; x52 -= l3.y * x13; x52 -= l3.z * x14; x52 -= l3.w * x15; x52 -= l4.x * x16; x52 -= l4.y * x17; x52 -= l4.z * x18; x52 -= l4.w * x19; x52 -= l5.x * x20; x52 -= l5.y * x21; x52 -= l5.z * x22; x52 -= l5.w * x23; x52 -= l6.x * x24; x52 -= l6.y * x25; x52 -= l6.z * x26; x52 -= l6.w * x27; x52 -= l7.x * x28; x52 -= l7.y * x29; x52 -= l7.z * x30; x52 -= l7.w * x31; } __builtin_amdgcn_sched_barrier(0); { const v4f l8 = GDN_L4(52, 8); const v4f l9 = GDN_L4(52, 9); const v4f l10 = GDN_L4(52, 10); const v4f l11 = GDN_L4(52, 11); const v4f l12 = GDN_L4(52, 12); __builtin_amdgcn_sched_barrier(0); x52 -= l8.x * x32; x52 -= l8.y * x33; x52 -= l8.z * x34; x52 -= l8.w * x35; x52 -= l9.x * x36; x52 -= l9.y * x37; x52 -= l9.z * x38; x52 -= l9.w * x39; x52 -= l10.x * x40; x52 -= l10.y * x41; x52 -= l10.z * x42; x52 -= l10.w * x43; x52 -= l11.x * x44; x52 -= l11.y * x45; x52 -= l11.z * x46; x52 -= l11.w * x47; x52 -= l12.x * x48; x52 -= l12.y * x49; x52 -= l12.z * x50; x52 -= l12.w * x51; } __builtin_amdgcn_sched_barrier(0);
        float x53 = GDN_RHS(53); { const v4f l0 = GDN_L4(53, 0); const v4f l1 = GDN_L4(53, 1); const v4f l2 = GDN_L4(53, 2); const v4f l3 = GDN_L4(53, 3); const v4f l4 = GDN_L4(53, 4); const v4f l5 = GDN_L4(53, 5); const v4f l6 = GDN_L4(53, 6); const v4f l7 = GDN_L4(53, 7); __builtin_amdgcn_sched_barrier(0); x53 -= l0.x * x0; x53 -= l0.y * x1; x53 -= l0.z * x2; x53 -= l0.w * x3; x53 -= l1.x * x4; x53 -= l1.y * x5; x53 -= l1.z * x6; x53 -= l1.w * x7; x53 -= l2.x * x8; x53 -= l2.y * x9; x53 -= l2.z * x10; x53 -= l2.w * x11; x53 -= l3.x * x12; x53 -= l3.y * x13; x53 -= l3.z * x14; x53 -= l3.w * x15; x53 -= l4.x * x16; x53 -= l4.y * x17; x53 -= l4.z * x18; x53 -= l4.w * x19; x53 -= l5.x * x20; x53 -= l5.y * x21; x53 -= l5.z * x22; x53 -= l5.w * x23; x53 -= l6.x * x24; x53 -= l6.y * x25; x53 -= l6.z * x26; x53 -= l6.w * x27; x53 -= l7.x * x28; x53 -= l7.y * x29; x53 -= l7.z * x30; x53 -= l7.w * x31; } __builtin_amdgcn_sched_barrier(0); { const v4f l8 = GDN_L4(53, 8); const v4f l9 = GDN_L4(53, 9); const v4f l10 = GDN_L4(53, 10); const v4f l11 = GDN_L4(53, 11); const v4f l12 = GDN_L4(53, 12); const v4f l13 = GDN_L4(53, 13); __builtin_amdgcn_sched_barrier(0); x53 -= l8.x * x32; x53 -= l8.y * x33; x53 -= l8.z * x34; x53 -= l8.w * x35; x53 -= l9.x * x36; x53 -= l9.y * x37; x53 -= l9.z * x38; x53 -= l9.w * x39; x53 -= l10.x * x40; x53 -= l10.y * x41; x53 -= l10.z * x42; x53 -= l10.w * x43; x53 -= l11.x * x44; x53 -= l11.y * x45; x53 -= l11.z * x46; x53 -= l11.w * x47; x53 -= l12.x * x48; x53 -= l12.y * x49; x53 -= l12.z * x50; x53 -= l12.w * x51; x53 -= l13.x * x52; } __builtin_amdgcn_sched_barrier(0);
        float x54 = GDN_RHS(54); { const v4f l0 = GDN_L4(54, 0); const v4f l1 = GDN_L4(54, 1); const v4f l2 = GDN_L4(54, 2); const v4f l3 = GDN_L4(54, 3); const v4f l4 = GDN_L4(54, 4); const v4f l5 = GDN_L4(54, 5); const v4f l6 = GDN_L4(54, 6); const v4f l7 = GDN_L4(54, 7); __builtin_amdgcn_sched_barrier(0); x54 -= l0.x * x0; x54 -= l0.y * x1; x54 -= l0.z * x2; x54 -= l0.w * x3; x54 -= l1.x * x4; x54 -= l1.y * x5; x54 -= l1.z * x6; x54 -= l1.w * x7; x54 -= l2.x * x8; x54 -= l2.y * x9; x54 -= l2.z * x10; x54 -= l2.w * x11; x54 -= l3.x * x12; x54 -= l3.y * x13; x54 -= l3.z * x14; x54 -= l3.w * x15; x54 -= l4.x * x16; x54 -= l4.y * x17; x54 -= l4.z * x18; x54 -= l4.w * x19; x54 -= l5.x * x20; x54 -= l5.y * x21; x54 -= l5.z * x22; x54 -= l5.w * x23; x54 -= l6.x * x24; x54 -= l6.y * x25; x54 -= l6.z * x26; x54 -= l6.w * x27; x54 -= l7.x * x28; x54 -= l7.y * x29; x54 -= l7.z * x30; x54 -= l7.w * x31; } __builtin_amdgcn_sched_barrier(0); { const v4f l8 = GDN_L4(54, 8); const v4f l9 = GDN_L4(54, 9); const v4f l10 = GDN_L4(54, 10); const v4f l11 = GDN_L4(54, 11); const v4f l12 = GDN_L4(54, 12); const v4f l13 = GDN_L4(54, 13); __builtin_amdgcn_sched_barrier(0); x54 -= l8.x * x32; x54 -= l8.y * x33; x54 -= l8.z * x34; x54 -= l8.w * x35; x54 -= l9.x * x36; x54 -= l9.y * x37; x54 -= l9.z * x38; x54 -= l9.w * x39; x54 -= l10.x * x40; x54 -= l10.y * x41; x54 -= l10.z * x42; x54 -= l10.w * x43; x54 -= l11.x * x44; x54 -= l11.y * x45; x54 -= l11.z * x46; x54 -= l11.w * x47; x54 -= l12.x * x48; x54 -= l12.y * x49; x54 -= l12.z * x50; x54 -= l12.w * x51; x54 -= l13.x * x52; x54 -= l13.y * x53; } __builtin_amdgcn_sched_barrier(0);
        float x55 = GDN_RHS(55); { const v4f l0 = GDN_L4(55, 0); const v4f l1 = GDN_L4(55, 1); const v4f l2 = GDN_L4(55, 2); const v4f l3 = GDN_L4(55, 3); const v4f l4 = GDN_L4(55, 4); const v4f l5 = GDN_L4(55, 5); const v4f l6 = GDN_L4(55, 6); const v4f l7 = GDN_L4(55, 7); __builtin_amdgcn_sched_barrier(0); x55 -= l0.x * x0; x55 -= l0.y * x1; x55 -= l0.z * x2; x55 -= l0.w * x3; x55 -= l1.x * x4; x55 -= l1.y * x5; x55 -= l1.z * x6; x55 -= l1.w * x7; x55 -= l2.x * x8; x55 -= l2.y * x9; x55 -= l2.z * x10; x55 -= l2.w * x11; x55 -= l3.x * x12; x55 -= l3.y * x13; x55 -= l3.z * x14; x55 -= l3.w * x15; x55 -= l4.x * x16; x55 -= l4.y * x17; x55 -= l4.z * x18; x55 -= l4.w * x19; x55 -= l5.x * x20; x55 -= l5.y * x21; x55 -= l5.z * x22; x55 -= l5.w * x23; x55 -= l6.x * x24; x55 -= l6.y * x25; x55 -= l6.z * x26; x55 -= l6.w * x27; x55 -= l7.x * x28; x55 -= l7.y * x29; x55 -= l7.z * x30; x55 -= l7.w * x31; } __builtin_amdgcn_sched_barrier(0); { const v4f l8 = GDN_L4(55, 8); const v4f l9 = GDN_L4(55, 9); const v4f l10 = GDN_L4(55, 10); const v4f l11 = GDN_L4(55, 11); const v4f l12 = GDN_L4(55, 12); const v4f l13 = GDN_L4(55, 13); __builtin_amdgcn_sched_barrier(0); x55 -= l8.x * x32; x55 -= l8.y * x33; x55 -= l8.z * x34; x55 -= l8.w * x35; x55 -= l9.x * x36; x55 -= l9.y * x37; x55 -= l9.z * x38; x55 -= l9.w * x39; x55 -= l10.x * x40; x55 -= l10.y * x41; x55 -= l10.z * x42; x55 -= l10.w * x43; x55 -= l11.x * x44; x55 -= l11.y * x45; x55 -= l11.z * x46; x55 -= l11.w * x47; x55 -= l12.x * x48; x55 -= l12.y * x49; x55 -= l12.z * x50; x55 -= l12.w * x51; x55 -= l13.x * x52; x55 -= l13.y * x53; x55 -= l13.z * x54; } __builtin_amdgcn_sched_barrier(0);
        float x56 = GDN_RHS(56); { const v4f l0 = GDN_L4(56, 0); const v4f l1 = GDN_L4(56, 1); const v4f l2 = GDN_L4(56, 2); const v4f l3 = GDN_L4(56, 3); const v4f l4 = GDN_L4(56, 4); const v4f l5 = GDN_L4(56, 5); const v4f l6 = GDN_L4(56, 6); const v4f l7 = GDN_L4(56, 7); __builtin_amdgcn_sched_barrier(0); x56 -= l0.x * x0; x56 -= l0.y * x1; x56 -= l0.z * x2; x56 -= l0.w * x3; x56 -= l1.x * x4; x56 -= l1.y * x5; x56 -= l1.z * x6; x56 -= l1.w * x7; x56 -= l2.x * x8; x56 -= l2.y * x9; x56 -= l2.z * x10; x56 -= l2.w * x11; x56 -= l3.x * x12; x56 -= l3.y * x13; x56 -= l3.z * x14; x56 -= l3.w * x15; x56 -= l4.x * x16; x56 -= l4.y * x17; x56 -= l4.z * x18; x56 -= l4.w * x19; x56 -= l5.x * x20; x56 -= l5.y * x21; x56 -= l5.z * x22; x56 -= l5.w * x23; x56 -= l6.x * x24; x56 -= l6.y * x25; x56 -= l6.z * x26; x56 -= l6.w * x27; x56 -= l7.x * x28; x56 -= l7.y * x29; x56 -= l7.z * x30; x56 -= l7.w * x31; } __builtin_amdgcn_sched_barrier(0); { const v4f l8 = GDN_L4(56, 8); const v4f l9 = GDN_L4(56, 9); const v4f l10 = GDN_L4(56, 10); const v4f l11 = GDN_L4(56, 11); const v4f l12 = GDN_L4(56, 12); const v4f l13 = GDN_L4(56, 13); __builtin_amdgcn_sched_barrier(0); x56 -= l8.x * x32; x56 -= l8.y * x33; x56 -= l8.z * x34; x56 -= l8.w * x35; x56 -= l9.x * x36; x56 -= l9.y * x37; x56 -= l9.z * x38; x56 -= l9.w * x39; x56 -= l10.x * x40; x56 -= l10.y * x41; x56 -= l10.z * x42; x56 -= l10.w * x43; x56 -= l11.x * x44; x56 -= l11.y * x45; x56 -= l11.z * x46; x56 -= l11.w * x47; x56 -= l12.x * x48; x56 -= l12.y * x49; x56 -= l12.z * x50; x56 -= l12.w * x51; x56 -= l13.x * x52; x56 -= l13.y * x53; x56 -= l13.z * x54; x56 -= l13.w * x55; } __builtin_amdgcn_sched_barrier(0);
        float x57 = GDN_RHS(57); { const v4f l0 = GDN_L4(57, 0); const v4f l1 = GDN_L4(57, 1); const v4f l2 = GDN_L4(57, 2); const v4f l3 = GDN_L4(57, 3); const v4f l4 = GDN_L4(57, 4); const v4f l5 = GDN_L4(57, 5); const v4f l6 = GDN_L4(57, 6); const v4f l7 = GDN_L4(57, 7); __builtin_amdgcn_sched_barrier(0); x57 -= l0.x * x0; x57 -= l0.y * x1; x57 -= l0.z * x2; x57 -= l0.w * x3; x57 -= l1.x * x4; x57 -= l1.y * x5; x57 -= l1.z * x6; x57 -= l1.w * x7; x57 -= l2.x * x8; x57 -= l2.y * x9; x57 -= l2.z * x10; x57 -= l2.w * x11; x57 -= l3.x * x12; x57 -= l3.y * x13; x57 -= l3.z * x14; x57 -= l3.w * x15; x57 -= l4.x * x16; x57 -= l4.y * x17; x57 -= l4.z * x18; x57 -= l4.w * x19; x57 -= l5.x * x20; x57 -= l5.y * x21; x57 -= l5.z * x22; x57 -= l5.w * x23; x57 -= l6.x * x24; x57 -= l6.y * x25; x57 -= l6.z * x26; x57 -= l6.w * x27; x57 -= l7.x * x28; x57 -= l7.y * x29; x57 -= l7.z * x30; x57 -= l7.w * x31; } __builtin_amdgcn_sched_barrier(0); { const v4f l8 = GDN_L4(57, 8); const v4f l9 = GDN_L4(57, 9); const v4f l10 = GDN_L4(57, 10); const v4f l11 = GDN_L4(57, 11); const v4f l12 = GDN_L4(57, 12); const v4f l13 = GDN_L4(57, 13); const v4f l14 = GDN_L4(57, 14); __builtin_amdgcn_sched_barrier(0); x57 -= l8.x * x32; x57 -= l8.y * x33; x57 -= l8.z * x34; x57 -= l8.w * x35; x57 -= l9.x * x36; x57 -= l9.y * x37; x57 -= l9.z * x38; x57 -= l9.w * x39; x57 -= l10.x * x40; x57 -= l10.y * x41; x57 -= l10.z * x42; x57 -= l10.w * x43; x57 -= l11.x * x44; x57 -= l11.y * x45; x57 -= l11.z * x46; x57 -= l11.w * x47; x57 -= l12.x * x48; x57 -= l12.y * x49; x57 -= l12.z * x50; x57 -= l12.w * x51; x57 -= l13.x * x52; x57 -= l13.y * x53; x57 -= l13.z * x54; x57 -= l13.w * x55; x57 -= l14.x * x56; } __builtin_amdgcn_sched_barrier(0);
        float x58 = GDN_RHS(58); { const v4f l0 = GDN_L4(58, 0); const v4f l1 = GDN_L4(58, 1); const v4f l2 = GDN_L4(58, 2); const v4f l3 = GDN_L4(58, 3); const v4f l4 = GDN_L4(58, 4); const v4f l5 = GDN_L4(58, 5); const v4f l6 = GDN_L4(58, 6); const v4f l7 = GDN_L4(58, 7); __builtin_amdgcn_sched_barrier(0); x58 -= l0.x * x0; x58 -= l0.y * x1; x58 -= l0.z * x2; x58 -= l0.w * x3; x58 -= l1.x * x4; x58 -= l1.y * x5; x58 -= l1.z * x6; x58 -= l1.w * x7; x58 -= l2.x * x8; x58 -= l2.y * x9; x58 -= l2.z * x10; x58 -= l2.w * x11; x58 -= l3.x * x12; x58 -= l3.y * x13; x58 -= l3.z * x14; x58 -= l3.w * x15; x58 -= l4.x * x16; x58 -= l4.y * x17; x58 -= l4.z * x18; x58 -= l4.w * x19; x58 -= l5.x * x20; x58 -= l5.y * x21; x58 -= l5.z * x22; x58 -= l5.w * x23; x58 -= l6.x * x24; x58 -= l6.y * x25; x58 -= l6.z * x26; x58 -= l6.w * x27; x58 -= l7.x * x28; x58 -= l7.y * x29; x58 -= l7.z * x30; x58 -= l7.w * x31; } __builtin_amdgcn_sched_barrier(0); { const v4f l8 = GDN_L4(58, 8); const v4f l9 = GDN_L4(58, 9); const v4f l10 = GDN_L4(58, 10); const v4f l11 = GDN_L4(58, 11); const v4f l12 = GDN_L4(58, 12); const v4f l13 = GDN_L4(58, 13); const v4f l14 = GDN_L4(58, 14); __builtin_amdgcn_sched_barrier(0); x58 -= l8.x * x32; x58 -= l8.y * x33; x58 -= l8.z * x34; x58 -= l8.w * x35; x58 -= l9.x * x36; x58 -= l9.y * x37; x58 -= l9.z * x38; x58 -= l9.w * x39; x58 -= l10.x * x40; x58 -= l10.y * x41; x58 -= l10.z * x42; x58 -= l10.w * x43; x58 -= l11.x * x44; x58 -= l11.y * x45; x58 -= l11.z * x46; x58 -= l11.w * x47; x58 -= l12.x * x48; x58 -= l12.y * x49; x58 -= l12.z * x50; x58 -= l12.w * x51; x58 -= l13.x * x52; x58 -= l13.y * x53; x58 -= l13.z * x54; x58 -= l13.w * x55; x58 -= l14.x * x56; x58 -= l14.y * x57; } __builtin_amdgcn_sched_barrier(0);
        float x59 = GDN_RHS(59); { const v4f l0 = GDN_L4(59, 0); const v4f l1 = GDN_L4(59, 1); const v4f l2 = GDN_L4(59, 2); const v4f l3 = GDN_L4(59, 3); const v4f l4 = GDN_L4(59, 4); const v4f l5 = GDN_L4(59, 5); const v4f l6 = GDN_L4(59, 6); const v4f l7 = GDN_L4(59, 7); __builtin_amdgcn_sched_barrier(0); x59 -= l0.x * x0; x59 -= l0.y * x1; x59 -= l0.z * x2; x59 -= l0.w * x3; x59 -= l1.x * x4; x59 -= l1.y * x5; x59 -= l1.z * x6; x59 -= l1.w * x7; x59 -= l2.x * x8; x59 -= l2.y * x9; x59 -= l2.z * x10; x59 -= l2.w * x11; x59 -= l3.x * x12; x59 -= l3.y * x13; x59 -= l3.z * x14; x59 -= l3.w * x15; x59 -= l4.x * x16; x59 -= l4.y * x17; x59 -= l4.z * x18; x59 -= l4.w * x19; x59 -= l5.x * x20; x59 -= l5.y * x21; x59 -= l5.z * x22; x59 -= l5.w * x23; x59 -= l6.x * x24; x59 -= l6.y * x25; x59 -= l6.z * x26; x59 -= l6.w * x27; x59 -= l7.x * x28; x59 -= l7.y * x29; x59 -= l7.z * x30; x59 -= l7.w * x31; } __builtin_amdgcn_sched_barrier(0); { const v4f l8 = GDN_L4(59, 8); const v4f l9 = GDN_L4(59, 9); const v4f l10 = GDN_L4(59, 10); const v4f l11 = GDN_L4(59, 11); const v4f l12 = GDN_L4(59, 12); const v4f l13 = GDN_L4(59, 13); const v4f l14 = GDN_L4(59, 14); __builtin_amdgcn_sched_barrier(0); x59 -= l8.x * x32; x59 -= l8.y * x33; x59 -= l8.z * x34; x59 -= l8.w * x35; x59 -= l9.x * x36; x59 -= l9.y * x37; x59 -= l9.z * x38; x59 -= l9.w * x39; x59 -= l10.x * x40; x59 -= l10.y * x41; x59 -= l10.z * x42; x59 -= l10.w * x43; x59 -= l11.x * x44; x59 -= l11.y * x45; x59 -= l11.z * x46; x59 -= l11.w * x47; x59 -= l12.x * x48; x59 -= l12.y * x49; x59 -= l12.z * x50; x59 -= l12.w * x51; x59 -= l13.x * x52; x59 -= l13.y * x53; x59 -= l13.z * x54; x59 -= l13.w * x55; x59 -= l14.x * x56; x59 -= l14.y * x57; x59 -= l14.z * x58; } __builtin_amdgcn_sched_barrier(0);
        float x60 = GDN_RHS(60); { const v4f l0 = GDN_L4(60, 0); const v4f l1 = GDN_L4(60, 1); const v4f l2 = GDN_L4(60, 2); const v4f l3 = GDN_L4(60, 3); const v4f l4 = GDN_L4(60, 4); const v4f l5 = GDN_L4(60, 5); const v4f l6 = GDN_L4(60, 6); const v4f l7 = GDN_L4(60, 7); __builtin_amdgcn_sched_barrier(0); x60 -= l0.x * x0; x60 -= l0.y * x1; x60 -= l0.z * x2; x60 -= l0.w * x3; x60 -= l1.x * x4; x60 -= l1.y * x5; x60 -= l1.z * x6; x60 -= l1.w * x7; x60 -= l2.x * x8; x60 -= l2.y * x9; x60 -= l2.z * x10; x60 -= l2.w * x11; x60 -= l3.x * x12; x60 -= l3.y * x13; x60 -= l3.z * x14; x60 -= l3.w * x15; x60 -= l4.x * x16; x60 -= l4.y * x17; x60 -= l4.z * x18; x60 -= l4.w * x19; x60 -= l5.x * x20; x60 -= l5.y * x21; x60 -= l5.z * x22; x60 -= l5.w * x23; x60 -= l6.x * x24; x60 -= l6.y * x25; x60 -= l6.z * x26; x60 -= l6.w * x27; x60 -= l7.x * x28; x60 -= l7.y * x29; x60 -= l7.z * x30; x60 -= l7.w * x31; } __builtin_amdgcn_sched_barrier(0); { const v4f l8 = GDN_L4(60, 8); const v4f l9 = GDN_L4(60, 9); const v4f l10 = GDN_L4(60, 10); const v4f l11 = GDN_L4(60, 11); const v4f l12 = GDN_L4(60, 12); const v4f l13 = GDN_L4(60, 13); const v4f l14 = GDN_L4(60, 14); __builtin_amdgcn_sched_barrier(0); x60 -= l8.x * x32; x60 -= l8.y * x33; x60 -= l8.z * x34; x60 -= l8.w * x35; x60 -= l9.x * x36; x60 -= l9.y * x37; x60 -= l9.z * x38; x60 -= l9.w * x39; x60 -= l10.x * x40; x60 -= l10.y * x41; x60 -= l10.z * x42; x60 -= l10.w * x43; x60 -= l11.x * x44; x60 -= l11.y * x45; x60 -= l11.z * x46; x60 -= l11.w * x47; x60 -= l12.x * x48; x60 -= l12.y * x49; x60 -= l12.z * x50; x60 -= l12.w * x51; x60 -= l13.x * x52; x60 -= l13.y * x53; x60 -= l13.z * x54; x60 -= l13.w * x55; x60 -= l14.x * x56; x60 -= l14.y * x57; x60 -= l14.z * x58; x60 -= l14.w * x59; } __builtin_amdgcn_sched_barrier(0);
        float x61 = GDN_RHS(61); { const v4f l0 = GDN_L4(61, 0); const v4f l1 = GDN_L4(61, 1); const v4f l2 = GDN_L4(61, 2); const v4f l3 = GDN_L4(61, 3); const v4f l4 = GDN_L4(61, 4); const v4f l5 = GDN_L4(61, 5); const v4f l6 = GDN_L4(61, 6); const v4f l7 = GDN_L4(61, 7); __builtin_amdgcn_sched_barrier(0); x61 -= l0.x * x0; x61 -= l0.y * x1; x61 -= l0.z * x2; x61 -= l0.w * x3; x61 -= l1.x * x4; x61 -= l1.y * x5; x61 -= l1.z * x6; x61 -= l1.w * x7; x61 -= l2.x * x8; x61 -= l2.y * x9; x61 -= l2.z * x10; x61 -= l2.w * x11; x61 -= l3.x * x12; x61 -= l3.y * x13; x61 -= l3.z * x14; x61 -= l3.w * x15; x61 -= l4.x * x16; x61 -= l4.y * x17; x61 -= l4.z * x18; x61 -= l4.w * x19; x61 -= l5.x * x20; x61 -= l5.y * x21; x61 -= l5.z * x22; x61 -= l5.w * x23; x61 -= l6.x * x24; x61 -= l6.y * x25; x61 -= l6.z * x26; x61 -= l6.w * x27; x61 -= l7.x * x28; x61 -= l7.y * x29; x61 -= l7.z * x30; x61 -= l7.w * x31; } __builtin_amdgcn_sched_barrier(0); { const v4f l8 = GDN_L4(61, 8); const v4f l9 = GDN_L4(61, 9); const v4f l10 = GDN_L4(61, 10); const v4f l11 = GDN_L4(61, 11); const v4f l12 = GDN_L4(61, 12); const v4f l13 = GDN_L4(61, 13); const v4f l14 = GDN_L4(61, 14); const v4f l15 = GDN_L4(61, 15); __builtin_amdgcn_sched_barrier(0); x61 -= l8.x * x32; x61 -= l8.y * x33; x61 -= l8.z * x34; x61 -= l8.w * x35; x61 -= l9.x * x36; x61 -= l9.y * x37; x61 -= l9.z * x38; x61 -= l9.w * x39; x61 -= l10.x * x40; x61 -= l10.y * x41; x61 -= l10.z * x42; x61 -= l10.w * x43; x61 -= l11.x * x44; x61 -= l11.y * x45; x61 -= l11.z * x46; x61 -= l11.w * x47; x61 -= l12.x * x48; x61 -= l12.y * x49; x61 -= l12.z * x50; x61 -= l12.w * x51; x61 -= l13.x * x52; x61 -= l13.y * x53; x61 -= l13.z * x54; x61 -= l13.w * x55; x61 -= l14.x * x56; x61 -= l14.y * x57; x61 -= l14.z * x58; x61 -= l14.w * x59; x61 -= l15.x * x60; } __builtin_amdgcn_sched_barrier(0);
        float x62 = GDN_RHS(62); { const v4f l0 = GDN_L4(62, 0); const v4f l1 = GDN_L4(62, 1); const v4f l2 = GDN_L4(62, 2); const v4f l3 = GDN_L4(62, 3); const v4f l4 = GDN_L4(62, 4); const v4f l5 = GDN_L4(62, 5); const v4f l6 = GDN_L4(62, 6); const v4f l7 = GDN_L4(62, 7); __builtin_amdgcn_sched_barrier(0); x62 -= l0.x * x0; x62 -= l0.y * x1; x62 -= l0.z * x2; x62 -= l0.w * x3; x62 -= l1.x * x4; x62 -= l1.y * x5; x62 -= l1.z * x6; x62 -= l1.w * x7; x62 -= l2.x * x8; x62 -= l2.y * x9; x62 -= l2.z * x10; x62 -= l2.w * x11; x62 -= l3.x * x12; x62 -= l3.y * x13; x62 -= l3.z * x14; x62 -= l3.w * x15; x62 -= l4.x * x16; x62 -= l4.y * x17; x62 -= l4.z * x18; x62 -= l4.w * x19; x62 -= l5.x * x20; x62 -= l5.y * x21; x62 -= l5.z * x22; x62 -= l5.w * x23; x62 -= l6.x * x24; x62 -= l6.y * x25; x62 -= l6.z * x26; x62 -= l6.w * x27; x62 -= l7.x * x28; x62 -= l7.y * x29; x62 -= l7.z * x30; x62 -= l7.w * x31; } __builtin_amdgcn_sched_barrier(0); { const v4f l8 = GDN_L4(62, 8); const v4f l9 = GDN_L4(62, 9); const v4f l10 = GDN_L4(62, 10); const v4f l11 = GDN_L4(62, 11); const v4f l12 = GDN_L4(62, 12); const v4f l13 = GDN_L4(62, 13); const v4f l14 = GDN_L4(62, 14); const v4f l15 = GDN_L4(62, 15); __builtin_amdgcn_sched_barrier(0); x62 -= l8.x * x32; x62 -= l8.y * x33; x62 -= l8.z * x34; x62 -= l8.w * x35; x62 -= l9.x * x36; x62 -= l9.y * x37; x62 -= l9.z * x38; x62 -= l9.w * x39; x62 -= l10.x * x40; x62 -= l10.y * x41; x62 -= l10.z * x42; x62 -= l10.w * x43; x62 -= l11.x * x44; x62 -= l11.y * x45; x62 -= l11.z * x46; x62 -= l11.w * x47; x62 -= l12.x * x48; x62 -= l12.y * x49; x62 -= l12.z * x50; x62 -= l12.w * x51; x62 -= l13.x * x52; x62 -= l13.y * x53; x62 -= l13.z * x54; x62 -= l13.w * x55; x62 -= l14.x * x56; x62 -= l14.y * x57; x62 -= l14.z * x58; x62 -= l14.w * x59; x62 -= l15.x * x60; x62 -= l15.y * x61; } __builtin_amdgcn_sched_barrier(0);
        float x63 = GDN_RHS(63); { const v4f l0 = GDN_L4(63, 0); const v4f l1 = GDN_L4(63, 1); const v4f l2 = GDN_L4(63, 2); const v4f l3 = GDN_L4(63, 3); const v4f l4 = GDN_L4(63, 4); const v4f l5 = GDN_L4(63, 5); const v4f l6 = GDN_L4(63, 6); const v4f l7 = GDN_L4(63, 7); __builtin_amdgcn_sched_barrier(0); x63 -= l0.x * x0; x63 -= l0.y * x1; x63 -= l0.z * x2; x63 -= l0.w * x3; x63 -= l1.x * x4; x63 -= l1.y * x5; x63 -= l1.z * x6; x63 -= l1.w * x7; x63 -= l2.x * x8; x63 -= l2.y * x9; x63 -= l2.z * x10; x63 -= l2.w * x11; x63 -= l3.x * x12; x63 -= l3.y * x13; x63 -= l3.z * x14; x63 -= l3.w * x15; x63 -= l4.x * x16; x63 -= l4.y * x17; x63 -= l4.z * x18; x63 -= l4.w * x19; x63 -= l5.x * x20; x63 -= l5.y * x21; x63 -= l5.z * x22; x63 -= l5.w * x23; x63 -= l6.x * x24; x63 -= l6.y * x25; x63 -= l6.z * x26; x63 -= l6.w * x27; x63 -= l7.x * x28; x63 -= l7.y * x29; x63 -= l7.z * x30; x63 -= l7.w * x31; } __builtin_amdgcn_sched_barrier(0); { const v4f l8 = GDN_L4(63, 8); const v4f l9 = GDN_L4(63, 9); const v4f l10 = GDN_L4(63, 10); const v4f l11 = GDN_L4(63, 11); const v4f l12 = GDN_L4(63, 12); const v4f l13 = GDN_L4(63, 13); const v4f l14 = GDN_L4(63, 14); const v4f l15 = GDN_L4(63, 15); __builtin_amdgcn_sched_barrier(0); x63 -= l8.x * x32; x63 -= l8.y * x33; x63 -= l8.z * x34; x63 -= l8.w * x35; x63 -= l9.x * x36; x63 -= l9.y * x37; x63 -= l9.z * x38; x63 -= l9.w * x39; x63 -= l10.x * x40; x63 -= l10.y * x41; x63 -= l10.z * x42; x63 -= l10.w * x43; x63 -= l11.x * x44; x63 -= l11.y * x45; x63 -= l11.z * x46; x63 -= l11.w * x47; x63 -= l12.x * x48; x63 -= l12.y * x49; x63 -= l12.z * x50; x63 -= l12.w * x51; x63 -= l13.x * x52; x63 -= l13.y * x53; x63 -= l13.z * x54; x63 -= l13.w * x55; x63 -= l14.x * x56; x63 -= l14.y * x57; x63 -= l14.z * x58; x63 -= l14.w * x59; x63 -= l15.x * x60; x63 -= l15.y * x61; x63 -= l15.z * x62; } __builtin_amdgcn_sched_barrier(0);
        if (c < 128) { GU[0 * 128 + c] = x0; GU[1 * 128 + c] = x1; GU[2 * 128 + c] = x2; GU[3 * 128 + c] = x3; GU[4 * 128 + c] = x4; GU[5 * 128 + c] = x5; GU[6 * 128 + c] = x6; GU[7 * 128 + c] = x7; GU[8 * 128 + c] = x8; GU[9 * 128 + c] = x9; GU[10 * 128 + c] = x10; GU[11 * 128 + c] = x11; GU[12 * 128 + c] = x12; GU[13 * 128 + c] = x13; GU[14 * 128 + c] = x14; GU[15 * 128 + c] = x15; GU[16 * 128 + c] = x16; GU[17 * 128 + c] = x17; GU[18 * 128 + c] = x18; GU[19 * 128 + c] = x19; GU[20 * 128 + c] = x20; GU[21 * 128 + c] = x21; GU[22 * 128 + c] = x22; GU[23 * 128 + c] = x23; GU[24 * 128 + c] = x24; GU[25 * 128 + c] = x25; GU[26 * 128 + c] = x26; GU[27 * 128 + c] = x27; GU[28 * 128 + c] = x28; GU[29 * 128 + c] = x29; GU[30 * 128 + c] = x30; GU[31 * 128 + c] = x31; GU[32 * 128 + c] = x32; GU[33 * 128 + c] = x33; GU[34 * 128 + c] = x34; GU[35 * 128 + c] = x35; GU[36 * 128 + c] = x36; GU[37 * 128 + c] = x37; GU[38 * 128 + c] = x38; GU[39 * 128 + c] = x39; GU[40 * 128 + c] = x40; GU[41 * 128 + c] = x41; GU[42 * 128 + c] = x42; GU[43 * 128 + c] = x43; GU[44 * 128 + c] = x44; GU[45 * 128 + c] = x45; GU[46 * 128 + c] = x46; GU[47 * 128 + c] = x47; GU[48 * 128 + c] = x48; GU[49 * 128 + c] = x49; GU[50 * 128 + c] = x50; GU[51 * 128 + c] = x51; GU[52 * 128 + c] = x52; GU[53 * 128 + c] = x53; GU[54 * 128 + c] = x54; GU[55 * 128 + c] = x55; GU[56 * 128 + c] = x56; GU[57 * 128 + c] = x57; GU[58 * 128 + c] = x58; GU[59 * 128 + c] = x59; GU[60 * 128 + c] = x60; GU[61 * 128 + c] = x61; GU[62 * 128 + c] = x62; GU[63 * 128 + c] = x63; }
        else { GNW[0 * 128 + (c - 128)] = (bf16)f2bf(-x0); GNW[1 * 128 + (c - 128)] = (bf16)f2bf(-x1); GNW[2 * 128 + (c - 128)] = (bf16)f2bf(-x2); GNW[3 * 128 + (c - 128)] = (bf16)f2bf(-x3); GNW[4 * 128 + (c - 128)] = (bf16)f2bf(-x4); GNW[5 * 128 + (c - 128)] = (bf16)f2bf(-x5); GNW[6 * 128 + (c - 128)] = (bf16)f2bf(-x6); GNW[7 * 128 + (c - 128)] = (bf16)f2bf(-x7); GNW[8 * 128 + (c - 128)] = (bf16)f2bf(-x8); GNW[9 * 128 + (c - 128)] = (bf16)f2bf(-x9); GNW[10 * 128 + (c - 128)] = (bf16)f2bf(-x10); GNW[11 * 128 + (c - 128)] = (bf16)f2bf(-x11); GNW[12 * 128 + (c - 128)] = (bf16)f2bf(-x12); GNW[13 * 128 + (c - 128)] = (bf16)f2bf(-x13); GNW[14 * 128 + (c - 128)] = (bf16)f2bf(-x14); GNW[15 * 128 + (c - 128)] = (bf16)f2bf(-x15); GNW[16 * 128 + (c - 128)] = (bf16)f2bf(-x16); GNW[17 * 128 + (c - 128)] = (bf16)f2bf(-x17); GNW[18 * 128 + (c - 128)] = (bf16)f2bf(-x18); GNW[19 * 128 + (c - 128)] = (bf16)f2bf(-x19); GNW[20 * 128 + (c - 128)] = (bf16)f2bf(-x20); GNW[21 * 128 + (c - 128)] = (bf16)f2bf(-x21); GNW[22 * 128 + (c - 128)] = (bf16)f2bf(-x22); GNW[23 * 128 + (c - 128)] = (bf16)f2bf(-x23); GNW[24 * 128 + (c - 128)] = (bf16)f2bf(-x24); GNW[25 * 128 + (c - 128)] = (bf16)f2bf(-x25); GNW[26 * 128 + (c - 128)] = (bf16)f2bf(-x26); GNW[27 * 128 + (c - 128)] = (bf16)f2bf(-x27); GNW[28 * 128 + (c - 128)] = (bf16)f2bf(-x28); GNW[29 * 128 + (c - 128)] = (bf16)f2bf(-x29); GNW[30 * 128 + (c - 128)] = (bf16)f2bf(-x30); GNW[31 * 128 + (c - 128)] = (bf16)f2bf(-x31); GNW[32 * 128 + (c - 128)] = (bf16)f2bf(-x32); GNW[33 * 128 + (c - 128)] = (bf16)f2bf(-x33); GNW[34 * 128 + (c - 128)] = (bf16)f2bf(-x34); GNW[35 * 128 + (c - 128)] = (bf16)f2bf(-x35); GNW[36 * 128 + (c - 128)] = (bf16)f2bf(-x36); GNW[37 * 128 + (c - 128)] = (bf16)f2bf(-x37); GNW[38 * 128 + (c - 128)] = (bf16)f2bf(-x38); GNW[39 * 128 + (c - 128)] = (bf16)f2bf(-x39); GNW[40 * 128 + (c - 128)] = (bf16)f2bf(-x40); GNW[41 * 128 + (c - 128)] = (bf16)f2bf(-x41); GNW[42 * 128 + (c - 128)] = (bf16)f2bf(-x42); GNW[43 * 128 + (c - 128)] = (bf16)f2bf(-x43); GNW[44 * 128 + (c - 128)] = (bf16)f2bf(-x44); GNW[45 * 128 + (c - 128)] = (bf16)f2bf(-x45); GNW[46 * 128 + (c - 128)] = (bf16)f2bf(-x46); GNW[47 * 128 + (c - 128)] = (bf16)f2bf(-x47); GNW[48 * 128 + (c - 128)] = (bf16)f2bf(-x48); GNW[49 * 128 + (c - 128)] = (bf16)f2bf(-x49); GNW[50 * 128 + (c - 128)] = (bf16)f2bf(-x50); GNW[51 * 128 + (c - 128)] = (bf16)f2bf(-x51); GNW[52 * 128 + (c - 128)] = (bf16)f2bf(-x52); GNW[53 * 128 + (c - 128)] = (bf16)f2bf(-x53); GNW[54 * 128 + (c - 128)] = (bf16)f2bf(-x54); GNW[55 * 128 + (c - 128)] = (bf16)f2bf(-x55); GNW[56 * 128 + (c - 128)] = (bf16)f2bf(-x56); GNW[57 * 128 + (c - 128)] = (bf16)f2bf(-x57); GNW[58 * 128 + (c - 128)] = (bf16)f2bf(-x58); GNW[59 * 128 + (c - 128)] = (bf16)f2bf(-x59); GNW[60 * 128 + (c - 128)] = (bf16)f2bf(-x60); GNW[61 * 128 + (c - 128)] = (bf16)f2bf(-x61); GNW[62 * 128 + (c - 128)] = (bf16)f2bf(-x62); GNW[63 * 128 + (c - 128)] = (bf16)f2bf(-x63); }
#undef GDN_RHS
#undef GDN_L4
    } else {
        const int t2 = tid - 256; const float gl = gcs[63];
        { const int i = t2 >> 2, d0 = (t2 & 3) * 32; const float e = __expf(gcs[i]);
#pragma unroll
          for (int x8 = 0; x8 < 4; ++x8) { const v4f a = *(const LAS v4f*)(qs + i * QP + d0 + 8 * x8), b = *(const LAS v4f*)(qs + i * QP + d0 + 8 * x8 + 4);
              v4u w; w.x = pk2(a.x * e, a.y * e); w.y = pk2(a.z * e, a.w * e); w.z = pk2(b.x * e, b.y * e); w.w = pk2(b.z * e, b.w * e); *(v4u*)(GQG + i * 128 + d0 + 8 * x8) = w; } }
        { const int d = t2 >> 1, j0 = (t2 & 1) * 32;
#pragma unroll
          for (int x8 = 0; x8 < 4; ++x8) { float o[8];
#pragma unroll
              for (int x = 0; x < 8; ++x) { const int j = j0 + 8 * x8 + x; o[x] = ks[j * QP + d] * __expf(gl - gcs[j]); }
              v4u w; w.x = pk2(o[0], o[1]); w.y = pk2(o[2], o[3]); w.z = pk2(o[4], o[5]); w.w = pk2(o[6], o[7]); *(v4u*)(GKT + d * 64 + j0 + 8 * x8) = w; } }
        if (t2 == 0) GDL[item] = __expf(gl);
    }
    __syncthreads();
}
struct GdnFrags { bf16x8_t nw[4], qg[4], at[2], kt[2][2]; float u[4]; float dl; };
__device__ __forceinline__ void gdn_load(GdnFrags& F, const Params& p, int item, int off128, int off64, int offk, int offu) {
    const bf16* GNW = (const bf16*)(p.ws + WS_GNW) + (size_t)item * 8192; const bf16* GQG = (const bf16*)(p.ws + WS_GQG) + (size_t)item * 8192;
    const bf16* GAT = (const bf16*)(p.ws + WS_GAT) + (size_t)item * 4096; const bf16* GKT = (const bf16*)(p.ws + WS_GKT) + (size_t)item * 8192; const float* GU = (const float*)(p.ws + WS_GU) + (size_t)item * 8192;
#pragma unroll
    for (int ks = 0; ks < 4; ++ks) { F.nw[ks] = *(const bf16x8_t*)(GNW + off128 + 32 * ks); F.qg[ks] = *(const bf16x8_t*)(GQG + off128 + 32 * ks); }
#pragma unroll
    for (int ks = 0; ks < 2; ++ks) { F.at[ks] = *(const bf16x8_t*)(GAT + off64 + 32 * ks); F.kt[0][ks] = *(const bf16x8_t*)(GKT + offk + 32 * ks); F.kt[1][ks] = *(const bf16x8_t*)(GKT + offk + 1024 + 32 * ks); }
#pragma unroll
    for (int r = 0; r < 4; ++r) F.u[r] = GU[offu + r * 128];
    F.dl = ((const float*)(p.ws + WS_GDL))[item];
}
constexpr int STP = 136, VNP = 72;
__device__ __forceinline__ void gdn_seq(const Params& p, LAS unsigned char* lds, int wgi, int wave, int lane) {
    const int u = wgi * 2 + (wave >> 2), wi = wave & 3, h = u >> 3, sl = u & 7, g = lane >> 4, c = lane & 15;
    LAS unsigned short* ST = (LAS unsigned short*)(lds + (wave >> 2) * 12288);
    LAS unsigned short* VNT = ST + 2 * 16 * STP;
    float* GO = (float*)(p.ws + WS_GO);
    const int off128 = (16 * wi + c) * 128 + 8 * g, off64 = (16 * wi + c) * 64 + 8 * g, offk = (32 * wi + c) * 64 + 8 * g, offu = (16 * wi + 4 * g) * 128 + 16 * sl + c;
#pragma unroll
    for (int mt = 0; mt < 2; ++mt) *(LAS v2u*)(ST + c * STP + 16 * (2 * wi + mt) + 4 * g) = (v2u){0u, 0u};
    pg8::f32x4 Sacc[2] = {{0.f, 0.f, 0.f, 0.f}, {0.f, 0.f, 0.f, 0.f}};
    __syncthreads();
    GdnFrags F0, F1;
    gdn_load(F0, p, h, off128, off64, offk, offu);
#define GDN_STEP(F, n_) do { const int cur = (n_) & 1; bf16x8_t sf[4]; \
        _Pragma("unroll") for (int ks = 0; ks < 4; ++ks) sf[ks] = *(const LAS bf16x8_t*)(ST + cur * 16 * STP + c * STP + 32 * ks + 8 * g); \
        pg8::f32x4 vn = {F.u[0], F.u[1], F.u[2], F.u[3]}; \
        _Pragma("unroll") for (int ks = 0; ks < 4; ++ks) vn = __builtin_amdgcn_mfma_f32_16x16x32_bf16(F.nw[ks], sf[ks], vn, 0, 0, 0); \
        { v2u w; w.x = pk2(vn[0], vn[1]); w.y = pk2(vn[2], vn[3]); *(LAS v2u*)(VNT + c * VNP + 16 * wi + 4 * g) = w; } \
        LDS_BAR(); \
        const bf16x8_t v0 = *(const LAS bf16x8_t*)(VNT + c * VNP + 8 * g), v1 = *(const LAS bf16x8_t*)(VNT + c * VNP + 32 + 8 * g); \
        pg8::f32x4 o = {0.f, 0.f, 0.f, 0.f}; \
        _Pragma("unroll") for (int ks = 0; ks < 4; ++ks) o = __builtin_amdgcn_mfma_f32_16x16x32_bf16(F.qg[ks], sf[ks], o, 0, 0, 0); \
        o = __builtin_amdgcn_mfma_f32_16x16x32_bf16(F.at[0], v0, o, 0, 0, 0); o = __builtin_amdgcn_mfma_f32_16x16x32_bf16(F.at[1], v1, o, 0, 0, 0); \
        { const size_t tb = (size_t)(n_) * 64 + 16 * wi + 4 * g; _Pragma("unroll") for (int r = 0; r < 4; ++r) GO[(tb + r) * BW + h * 128 + 16 * sl + c] = o[r]; } \
        _Pragma("unroll") for (int mt = 0; mt < 2; ++mt) { Sacc[mt] = Sacc[mt] * F.dl; \
            Sacc[mt] = __builtin_amdgcn_mfma_f32_16x16x32_bf16(F.kt[mt][0], v0, Sacc[mt], 0, 0, 0); Sacc[mt] = __builtin_amdgcn_mfma_f32_16x16x32_bf16(F.kt[mt][1], v1, Sacc[mt], 0, 0, 0); \
            v2u w; w.x = pk2(Sacc[mt][0], Sacc[mt][1]); w.y = pk2(Sacc[mt][2], Sacc[mt][3]); *(LAS v2u*)(ST + (cur ^ 1) * 16 * STP + c * STP + 16 * (2 * wi + mt) + 4 * g) = w; } \
        LDS_BAR(); } while (0)
    for (int n = 0; n < T / 64; n += 2) {
        gdn_load(F1, p, (n + 1) * 4 + h, off128, off64, offk, offu);
        GDN_STEP(F0, n);
        gdn_load(F0, p, ((n + 2 < T / 64) ? n + 2 : n) * 4 + h, off128, off64, offk, offu);
        GDN_STEP(F1, n + 1);
    }
#undef GDN_STEP
}

constexpr int SEQ_UOFF = 132096;
constexpr int GI_NW = 0, GI_QG = 8704, GI_AT = 17408, GI_KT = 22016, GI_SZ = 31232;
struct GdnStage { v4u r[7]; float u[4]; float dl; };
__device__ __forceinline__ void gdn_stage_load(GdnStage& Sg, const Params& p, int item, int tid, int offu) {
    const bf16* GNW = (const bf16*)(p.ws + WS_GNW) + (size_t)item * 8192; const bf16* GQG = (const bf16*)(p.ws + WS_GQG) + (size_t)item * 8192;
    const bf16* GAT = (const bf16*)(p.ws + WS_GAT) + (size_t)item * 4096; const bf16* GKT = (const bf16*)(p.ws + WS_GKT) + (size_t)item * 8192; const float* GU = (const float*)(p.ws + WS_GU) + (size_t)item * 8192;
    Sg.r[0] = *(const v4u*)(GNW + 8 * tid); Sg.r[1] = *(const v4u*)(GNW + 8 * (tid + 512)); Sg.r[2] = *(const v4u*)(GQG + 8 * tid); Sg.r[3] = *(const v4u*)(GQG + 8 * (tid + 512));
    Sg.r[4] = *(const v4u*)(GAT + 8 * tid); Sg.r[5] = *(const v4u*)(GKT + 8 * tid); Sg.r[6] = *(const v4u*)(GKT + 8 * (tid + 512));
#pragma unroll
    for (int r = 0; r < 4; ++r) Sg.u[r] = GU[offu + r * 128];
    Sg.dl = ((const float*)(p.ws + WS_GDL))[item];
}
__device__ __forceinline__ void gdn_stage_write(const GdnStage& Sg, LAS unsigned short* img, int tid) {
    { const int p0 = tid, p1 = tid + 512;
      *(LAS v4u*)(img + GI_NW + (p0 >> 4) * 136 + 8 * (p0 & 15)) = Sg.r[0]; *(LAS v4u*)(img + GI_NW + (p1 >> 4) * 136 + 8 * (p1 & 15)) = Sg.r[1];
      *(LAS v4u*)(img + GI_QG + (p0 >> 4) * 136 + 8 * (p0 & 15)) = Sg.r[2]; *(LAS v4u*)(img + GI_QG + (p1 >> 4) * 136 + 8 * (p1 & 15)) = Sg.r[3];
      *(LAS v4u*)(img + GI_AT + (p0 >> 3) * 72 + 8 * (p0 & 7)) = Sg.r[4];
      *(LAS v4u*)(img + GI_KT + (p0 >> 3) * 72 + 8 * (p0 & 7)) = Sg.r[5]; *(LAS v4u*)(img + GI_KT + (p1 >> 3) * 72 + 8 * (p1 & 7)) = Sg.r[6]; }
}
__device__ __forceinline__ void gdn_seq2(const Params& p, LAS unsigned char* lds, int wgi, int tid, int wave, int lane) {
    const int h = wgi >> 2, sl = 2 * (wgi & 3) + (wave >> 2), wi = wave & 3, g = lane >> 4, c = lane & 15;
    LAS unsigned short* IMG = (LAS unsigned short*)lds;
    LAS unsigned short* ST = (LAS unsigned short*)(lds + SEQ_UOFF + (wave >> 2) * 12288);
    LAS unsigned short* VNT = ST + 2 * 16 * STP;
    float* GO = (float*)(p.ws + WS_GO);
    const int offu = (16 * wi + 4 * g) * 128 + 16 * sl + c;
#pragma unroll
    for (int mt = 0; mt < 2; ++mt) *(LAS v2u*)(ST + c * STP + 16 * (2 * wi + mt) + 4 * g) = (v2u){0u, 0u};
    pg8::f32x4 Sacc[2] = {{0.f, 0.f, 0.f, 0.f}, {0.f, 0.f, 0.f, 0.f}};
    GdnStage A, B;
    gdn_stage_load(A, p, h, tid, offu); gdn_stage_write(A, IMG, tid);
    gdn_stage_load(B, p, 4 + h, tid, offu);
    LDS_BAR();
    constexpr int NCH = T / 64;
#define GDN_STEP2(X, Y, n_) do { const int cur = (n_) & 1; const LAS unsigned short* im = IMG + cur * GI_SZ; bf16x8_t sf[4]; \
        _Pragma("unroll") for (int ks = 0; ks < 4; ++ks) sf[ks] = *(const LAS bf16x8_t*)(ST + cur * 16 * STP + c * STP + 32 * ks + 8 * g); \
        pg8::f32x4 vn = {X.u[0], X.u[1], X.u[2], X.u[3]}; const float dl = X.dl; \
        _Pragma("unroll") for (int ks = 0; ks < 4; ++ks) vn = __builtin_amdgcn_mfma_f32_16x16x32_bf16(*(const LAS bf16x8_t*)(im + GI_NW + (16 * wi + c) * 136 + 32 * ks + 8 * g), sf[ks], vn, 0, 0, 0); \
        { v2u w; w.x = pk2(vn[0], vn[1]); w.y = pk2(vn[2], vn[3]); *(LAS v2u*)(VNT + c * VNP + 16 * wi + 4 * g) = w; } \
        pg8::f32x4 o = {0.f, 0.f, 0.f, 0.f}; \
        _Pragma("unroll") for (int ks = 0; ks < 4; ++ks) o = __builtin_amdgcn_mfma_f32_16x16x32_bf16(*(const LAS bf16x8_t*)(im + GI_QG + (16 * wi + c) * 136 + 32 * ks + 8 * g), sf[ks], o, 0, 0, 0); \
        LDS_BAR(); \
        gdn_stage_load(X, p, (((n_) + 2 < NCH) ? (n_) + 2 : (n_)) * 4 + h, tid, offu); \
        const bf16x8_t v0 = *(const LAS bf16x8_t*)(VNT + c * VNP + 8 * g), v1 = *(const LAS bf16x8_t*)(VNT + c * VNP + 32 + 8 * g); \
        o = __builtin_amdgcn_mfma_f32_16x16x32_bf16(*(const LAS bf16x8_t*)(im + GI_AT + (16 * wi + c) * 72 + 8 * g), v0, o, 0, 0, 0); \
        o = __builtin_amdgcn_mfma_f32_16x16x32_bf16(*(const LAS bf16x8_t*)(im + GI_AT + (16 * wi + c) * 72 + 32 + 8 * g), v1, o, 0, 0, 0); \
        { const size_t tb = (size_t)(n_) * 64 + 16 * wi + 4 * g; _Pragma("unroll") for (int r = 0; r < 4; ++r) GO[(tb + r) * BW + h * 128 + 16 * sl + c] = o[r]; } \
        _Pragma("unroll") for (int mt = 0; mt < 2; ++mt) { Sacc[mt] = Sacc[mt] * dl; \
            Sacc[mt] = __builtin_amdgcn_mfma_f32_16x16x32_bf16(*(const LAS bf16x8_t*)(im + GI_KT + (16 * (2 * wi + mt) + c) * 72 + 8 * g), v0, Sacc[mt], 0, 0, 0); \
            Sacc[mt] = __builtin_amdgcn_mfma_f32_16x16x32_bf16(*(const LAS bf16x8_t*)(im + GI_KT + (16 * (2 * wi + mt) + c) * 72 + 32 + 8 * g), v1, Sacc[mt], 0, 0, 0); \
            v2u w; w.x = pk2(Sacc[mt][0], Sacc[mt][1]); w.y = pk2(Sacc[mt][2], Sacc[mt][3]); *(LAS v2u*)(ST + (cur ^ 1) * 16 * STP + c * STP + 16 * (2 * wi + mt) + 4 * g) = w; } \
        gdn_stage_write(Y, IMG + (cur ^ 1) * GI_SZ, tid); \
        LDS_BAR(); } while (0)
    for (int n = 0; n < NCH; n += 2) { GDN_STEP2(A, B, n); GDN_STEP2(B, A, n + 1); }
#undef GDN_STEP2
}
constexpr int MI_Q = 0, MI_S = 4608, MI_K = 9216, MI_SZ = 13824;
struct MlStage { v4u r[3]; bf16x8_t vt[2]; float fl; };
__device__ __forceinline__ void ml_stage_load(MlStage& Sg, const Params& p, int item, int tid, int offV) {
    const bf16* MQ = (const bf16*)(p.ws + WS_MQ) + (size_t)item * 4096; const bf16* MS = (const bf16*)(p.ws + WS_MS) + (size_t)item * 4096; const bf16* MK = (const bf16*)(p.ws + WS_MK) + (size_t)item * 4096;
    const bf16* MV = (const bf16*)(p.ws + WS_MV) + (size_t)item * 9216;
    Sg.r[0] = *(const v4u*)(MQ + 8 * tid); Sg.r[1] = *(const v4u*)(MS + 8 * tid); Sg.r[2] = *(const v4u*)(MK + 8 * tid);
    Sg.vt[0] = *(const bf16x8_t*)(MV + offV); Sg.vt[1] = *(const bf16x8_t*)(MV + offV + 32);
    Sg.fl = ((const float*)(p.ws + WS_MFL))[item];
}
__device__ __forceinline__ void ml_stage_write(const MlStage& Sg, LAS unsigned short* img, int tid) {
    const int o = (tid >> 3) * 72 + 8 * (tid & 7);
    *(LAS v4u*)(img + MI_Q + o) = Sg.r[0]; *(LAS v4u*)(img + MI_S + o) = Sg.r[1]; *(LAS v4u*)(img + MI_K + o) = Sg.r[2];
}
__device__ __forceinline__ void ml_seq2(const Params& p, LAS unsigned char* lds, int wgi, int tid, int wave, int lane) {
    const int h = wgi / 5, sl0 = 2 * (wgi % 5) + (wave >> 2), wi = wave & 3, g = lane >> 4, c = lane & 15;
    const bool real = sl0 < 9; const int sl = real ? sl0 : 8;
    LAS unsigned short* IMG = (LAS unsigned short*)lds;
    LAS unsigned short* CT = (LAS unsigned short*)(lds + SEQ_UOFF + (wave >> 2) * 8192);
    float* HO = (float*)(p.ws + WS_HO); float* HDEN = (float*)(p.ws + WS_HDEN);
    const int offV = (16 * sl + c) * 64 + 8 * g;
    *(LAS v2u*)(CT + c * 72 + 16 * wi + 4 * g) = (v2u){0u, 0u};
    pg8::f32x4 Cacc = {0.f, 0.f, 0.f, 0.f};
    MlStage A, B;
    ml_stage_load(A, p, h, tid, offV); ml_stage_write(A, IMG, tid);
    ml_stage_load(B, p, 4 + h, tid, offV);
    LDS_BAR();
    constexpr int NCH = T / 64;
#define ML_STEP2(X, Y, n_) do { const int cur = (n_) & 1; const LAS unsigned short* im = IMG + cur * MI_SZ; const int ro = (16 * wi + c) * 72 + 8 * g; \
        const bf16x8_t c0 = *(const LAS bf16x8_t*)(CT + cur * 16 * 72 + c * 72 + 8 * g), c1 = *(const LAS bf16x8_t*)(CT + cur * 16 * 72 + c * 72 + 32 + 8 * g); \
        const bf16x8_t vt0 = X.vt[0], vt1 = X.vt[1]; const float fl = X.fl; \
        pg8::f32x4 num = {0.f, 0.f, 0.f, 0.f}; \
        num = __builtin_amdgcn_mfma_f32_16x16x32_bf16(*(const LAS bf16x8_t*)(im + MI_Q + ro), c0, num, 0, 0, 0); num = __builtin_amdgcn_mfma_f32_16x16x32_bf16(*(const LAS bf16x8_t*)(im + MI_Q + ro + 32), c1, num, 0, 0, 0); \
        num = __builtin_amdgcn_mfma_f32_16x16x32_bf16(*(const LAS bf16x8_t*)(im + MI_S + ro), vt0, num, 0, 0, 0); num = __builtin_amdgcn_mfma_f32_16x16x32_bf16(*(const LAS bf16x8_t*)(im + MI_S + ro + 32), vt1, num, 0, 0, 0); \
        Cacc = Cacc * fl; \
        Cacc = __builtin_amdgcn_mfma_f32_16x16x32_bf16(*(const LAS bf16x8_t*)(im + MI_K + ro), vt0, Cacc, 0, 0, 0); Cacc = __builtin_amdgcn_mfma_f32_16x16x32_bf16(*(const LAS bf16x8_t*)(im + MI_K + ro + 32), vt1, Cacc, 0, 0, 0); \
        ml_stage_load(X, p, (((n_) + 2 < NCH) ? (n_) + 2 : (n_)) * 4 + h, tid, offV); \
        { v2u w; w.x = pk2(Cacc[0], Cacc[1]); w.y = pk2(Cacc[2], Cacc[3]); *(LAS v2u*)(CT + (cur ^ 1) * 16 * 72 + c * 72 + 16 * wi + 4 * g) = w; } \
        { const size_t tb = (size_t)(n_) * 64 + 16 * wi + 4 * g; \
          if (sl < 8) { _Pragma("unroll") for (int r = 0; r < 4; ++r) HO[(tb + r) * BW + h * 128 + 16 * sl + c] = num[r]; } \
          else if (c == 0 && real) { _Pragma("unroll") for (int r = 0; r < 4; ++r) HDEN[(tb + r) * 4 + h] = num[r]; } } \
        ml_stage_write(Y, IMG + (cur ^ 1) * MI_SZ, tid); \
        LDS_BAR(); } while (0)
    for (int n = 0; n < NCH; n += 2) { ML_STEP2(A, B, n); ML_STEP2(B, A, n + 1); }
#undef ML_STEP2
}

__device__ __forceinline__ void mixer_gmlp_item(const Params& p, int l, LAS unsigned char* lds, int item, int tid, int wave, int lane) {
    const int chunk = item >> 2, g = item & 3; const size_t tok0 = (size_t)chunk * 128;
    const bf16* Z = (const bf16*)(p.ws + WS_Z); bf16* BR1 = (bf16*)(p.ws + WS_BR) + 1 * BW;
    const float* ng = p.in[I_GMNG] + l * BW; const float* nb = p.in[I_GMNB] + l * BW;
    const float* wsp = p.in[I_GMWS] + ((size_t)(l * 4 + g) * 128) * 128; const float* bsp = p.in[I_GMBS] + (l * 4 + g) * 128;
    LAS float* vn = (LAS float*)lds;
    for (int r = 0; r < 16; ++r) { const int tk = wave * 16 + r;
        const v4u raw = *(const v4u*)(Z + (tok0 + tk) * ZC + ZC_GMV + 8 * lane); float x[8]; unpack8(raw, x); float s = 0.f;
#pragma unroll
        for (int i = 0; i < 8; ++i) { x[i] = gelu_tanh(x[i]); s += x[i]; }
        const float mean = wave_sum(s) * (1.f / 512.f); float ss = 0.f;
#pragma unroll
        for (int i = 0; i < 8; ++i) { x[i] -= mean; ss += x[i] * x[i]; }
        const float rstd = rsqrtf(wave_sum(ss) * (1.f / 512.f) + LN_EPS);
        if ((lane >> 4) == g) { const int cl = 8 * (lane & 15);
#pragma unroll
            for (int i = 0; i < 8; ++i) vn[tk * 128 + cl + i] = x[i] * rstd * ng[8 * lane + i] + nb[8 * lane + i]; }
    }
    __syncthreads();
    const int t = tid >> 2, cq = tid & 3; float acc[32];
#pragma unroll
    for (int i = 0; i < 32; ++i) acc[i] = 0.f;
    const float* wrow = wsp + (size_t)t * 128;
    for (int s = 0; s <= t; ++s) { const float w = wrow[s]; const LAS float* row = vn + s * 128 + cq * 32;
#pragma unroll
        for (int i4 = 0; i4 < 8; ++i4) { const v4f a = *(const LAS v4f*)(row + 4 * i4); acc[4 * i4] += w * a.x; acc[4 * i4 + 1] += w * a.y; acc[4 * i4 + 2] += w * a.z; acc[4 * i4 + 3] += w * a.w; } }
    const float bias = bsp[t];
#pragma unroll
    for (int i8 = 0; i8 < 4; ++i8) { const v4u raw = *(const v4u*)(Z + (tok0 + t) * ZC + ZC_GMU + g * 128 + cq * 32 + 8 * i8); float u[8]; unpack8(raw, u); float o[8];
#pragma unroll
        for (int i = 0; i < 8; ++i) o[i] = gelu_tanh(u[i]) * (acc[8 * i8 + i] + bias);
#if MERGE_FP8
        *(v2u*)((unsigned char*)(p.ws + WS_BR) + (tok0 + t) * BRW + 1 * BW + g * 128 + cq * 32 + 8 * i8) = (v2u){pk4_f8(o[0], o[1], o[2], o[3], BRSC), pk4_f8(o[4], o[5], o[6], o[7], BRSC)}; }
#else
        v4u w; w.x = pk2(o[0], o[1]); w.y = pk2(o[2], o[3]); w.z = pk2(o[4], o[5]); w.w = pk2(o[6], o[7]);
        *(v4u*)(BR1 + (tok0 + t) * BRW + g * 128 + cq * 32 + 8 * i8) = w; }
#endif
    __syncthreads();
}

__device__ __forceinline__ void vt_item(const Params& p, LAS unsigned char* lds, int item, int tid) {
    const int h = item & 3, n = item >> 2; const size_t t0 = (size_t)n * 64;
    const bf16* Z = (const bf16*)(p.ws + WS_Z); bf16* VT = (bf16*)(p.ws + WS_VT);
    LAS unsigned short* vs = (LAS unsigned short*)lds;
#pragma unroll
    for (int r = 0; r < 2; ++r) { const int idx = tid + 512 * r, tk = idx >> 4, c8 = idx & 15;
        *(LAS v4u*)(vs + tk * 136 + 8 * c8) = *(const v4u*)(Z + (t0 + tk) * ZC + ZC_SBV + h * 128 + 8 * c8); }
    __syncthreads();
    { const int d = tid >> 2, jq = tid & 3; unsigned w[8];
#pragma unroll
      for (int x = 0; x < 8; ++x) w[x] = (unsigned)vs[(16 * jq + 2 * x) * 136 + d] | ((unsigned)vs[(16 * jq + 2 * x + 1) * 136 + d] << 16);
      bf16* dst = VT + ((size_t)h * 128 + d) * T + t0 + 16 * jq;
      *(v4u*)dst = (v4u){w[0], w[1], w[2], w[3]}; *(v4u*)(dst + 8) = (v4u){w[4], w[5], w[6], w[7]}; }
    __syncthreads();
}
constexpr int KTP = 136, VTP = 72;
__device__ __forceinline__ void sb_unit(const Params& p, LAS unsigned char* lds, int unit, int tid, int wave, int lane) {
    const int h = unit >> 6, q0 = (unit & 63) * 128, g = lane >> 4, c = lane & 15; const int qrow = q0 + 16 * wave + c;
    const bf16* Z = (const bf16*)(p.ws + WS_Z); const bf16* VT = (const bf16*)(p.ws + WS_VT) + (size_t)h * 128 * T; bf16* BR0 = (bf16*)(p.ws + WS_BR);
    LAS unsigned short* Kt = (LAS unsigned short*)lds;
    LAS unsigned short* Vt = Kt + 2 * 64 * KTP;
    LAS int* flags = (LAS int*)(Vt + 2 * 128 * VTP);
    bf16x8_t qf[4];
#pragma unroll
    for (int ks = 0; ks < 4; ++ks) qf[ks] = *(const bf16x8_t*)(Z + (size_t)qrow * ZC + ZC_SBQ + h * 128 + 32 * ks + 8 * g);
    pg8::f32x4 acc[8];
#pragma unroll
    for (int dt = 0; dt < 8; ++dt) acc[dt] = (pg8::f32x4){0.f, 0.f, 0.f, 0.f};
    float racc = 0.f;
    v4u kr[2], vr[2];
    const int jt = (q0 >> 6) + 1;
#define SB_GLOAD(j_) do { _Pragma("unroll") for (int r = 0; r < 2; ++r) { const int idx = tid + 512 * r; \
        kr[r] = *(const v4u*)(Z + (size_t)(64 * (j_) + (idx >> 4)) * ZC + ZC_SBK + h * 128 + 8 * (idx & 15)); \
        vr[r] = *(const v4u*)(VT + (size_t)(idx >> 3) * T + 64 * (j_) + 8 * (idx & 7)); } } while (0)
#define SB_LWRITE(b_) do { _Pragma("unroll") for (int r = 0; r < 2; ++r) { const int idx = tid + 512 * r; \
        *(LAS v4u*)(Kt + (b_) * 64 * KTP + (idx >> 4) * KTP + 8 * (idx & 15)) = kr[r]; *(LAS v4u*)(Vt + (b_) * 128 * VTP + (idx >> 3) * VTP + 8 * (idx & 7)) = vr[r]; } } while (0)
    LDS_BAR();
    SB_GLOAD(jt); SB_LWRITE(0);
    LDS_BAR();
    for (int j = jt, it = 0; j >= 0; --j, ++it) {
        const int cur = it & 1;
        SB_GLOAD(j > 0 ? j - 1 : 0);
        const bool wdone = __all(racc > 104.f);
        if (64 * j < q0 + 16 * wave + 15 && !wdone) {
            const LAS unsigned short* Kc = Kt + cur * 64 * KTP; const LAS unsigned short* Vc = Vt + cur * 128 * VTP;
            pg8::f32x4 z[4];
#pragma unroll
            for (int s = 0; s < 4; ++s) { z[s] = (pg8::f32x4){0.f, 0.f, 0.f, 0.f};
#pragma unroll
                for (int ks = 0; ks < 4; ++ks) z[s] = __builtin_amdgcn_mfma_f32_16x16x32_bf16(*(const LAS bf16x8_t*)(Kc + (16 * s + c) * KTP + 32 * ks + 8 * g), qf[ks], z[s], 0, 0, 0); }
            float sp[4][4], t[4], xs[4]; bool mk[4][4];
#pragma unroll
            for (int s = 0; s < 4; ++s) { t[s] = 0.f;
#pragma unroll
                for (int r = 0; r < 4; ++r) { const int key = 64 * j + 16 * s + 4 * g + r; mk[s][r] = key < qrow; const float zz = z[s][r] * 0.08838834764831845f; z[s][r] = zz;
                    sp[s][r] = mk[s][r] ? softplusf_(zz) : 0.f; t[s] += sp[s][r]; } }
            float grand = 0.f, higher[4];
#pragma unroll
            for (int s = 3; s >= 0; --s) { float x = t[s]; float y = __shfl(x, lane + 16); x += (g < 3) ? y : 0.f; y = __shfl(x, lane + 32); x += (g < 2) ? y : 0.f;
                xs[s] = x - t[s];
                const float tot = __shfl(x, c); higher[s] = grand; grand += tot; }
            bf16x8_t pf[2];
#pragma unroll
            for (int s = 0; s < 4; ++s) { float a[4]; float e = 0.f;
#pragma unroll
                for (int r = 3; r >= 0; --r) { const float la = z[s][r] - sp[s][r] - (racc + higher[s] + xs[s] + e); a[r] = mk[s][r] ? __expf(la) : 0.f; e += sp[s][r]; }
                const unsigned w0 = pk2(a[0], a[1]), w1 = pk2(a[2], a[3]);
                if ((s & 1) == 0) { pf[s >> 1][0] = (short)(w0 & 0xffff); pf[s >> 1][1] = (short)(w0 >> 16); pf[s >> 1][2] = (short)(w1 & 0xffff); pf[s >> 1][3] = (short)(w1 >> 16); }
                else              { pf[s >> 1][4] = (short)(w0 & 0xffff); pf[s >> 1][5] = (short)(w0 >> 16); pf[s >> 1][6] = (short)(w1 & 0xffff); pf[s >> 1][7] = (short)(w1 >> 16); } }
            racc += grand;
#pragma unroll
            for (int dt = 0; dt < 8; ++dt)
#pragma unroll
                for (int k2 = 0; k2 < 2; ++k2) { const v2u lo = *(const LAS v2u*)(Vc + (16 * dt + c) * VTP + 32 * k2 + 4 * g), hi = *(const LAS v2u*)(Vc + (16 * dt + c) * VTP + 32 * k2 + 16 + 4 * g);
                    const v4u vv = (v4u){lo.x, lo.y, hi.x, hi.y};
                    acc[dt] = __builtin_amdgcn_mfma_f32_16x16x32_bf16(__builtin_bit_cast(bf16x8_t, vv), pf[k2], acc[dt], 0, 0, 0); }
        }
        const bool wd2 = __all(racc > 104.f);
        if (lane == 0) flags[cur * 8 + wave] = wd2 ? 1 : 0;
        SB_LWRITE(cur ^ 1);
        LDS_BAR();
        int alld = 1;
#pragma unroll
        for (int w = 0; w < 8; ++w) alld &= flags[cur * 8 + w];
        if (alld) break;
    }
#undef SB_GLOAD
#undef SB_LWRITE
#pragma unroll
#if MERGE_FP8
    for (int dt = 0; dt < 8; ++dt) *(unsigned*)((unsigned char*)BR0 + (size_t)qrow * BRW + h * 128 + 16 * dt + 4 * g) = pk4_f8(acc[dt][0], acc[dt][1], acc[dt][2], acc[dt][3], BRSC);
#else
    for (int dt = 0; dt < 8; ++dt) { v2u w; w.x = pk2(acc[dt][0], acc[dt][1]); w.y = pk2(acc[dt][2], acc[dt][3]); *(v2u*)(BR0 + (size_t)qrow * BRW + h * 128 + 16 * dt + 4 * g) = w; }
#endif
}

__device__ __forceinline__ void phase_mixers(const Params& p, int l, LAS unsigned char* lds, int wg, int G, int tid, int wave, int lane, const XcdBarrier& bar) {
#if defined(PROBE_SPLIT)
    if (wg < 16) gdn_seq2(p, lds, wg, tid, wave, lane); else if (wg < 36) ml_seq2(p, lds, wg - 16, tid, wave, lane);
    xcd_barrier(bar);
    const int w2 = wg, G2 = G;
#else
    if (wg < 16) { gdn_seq2(p, lds, wg, tid, wave, lane); return; }
    if (wg < 36) { ml_seq2(p, lds, wg - 16, tid, wave, lane); return; }
    const int w2 = wg - 36, G2 = G - 36;
#endif
    for (int it = w2; it < 256; it += G2) mixer_gmlp_item(p, l, lds, it, tid, wave, lane);
    for (int it = w2; it < 256; it += G2) sb_unit(p, lds, it, tid, wave, lane);
#if !defined(PROBE_CONV0)
    __syncthreads();
#if defined(PROBE_CONVDUP)
#pragma nounroll
    for (int rep = 0; rep < 2; ++rep)
#endif
    phase_convert<1>(p, l, lds, w2 * 8 + wave, G2 * 8, wave, lane
#if defined(PROBE_CONVDUP)
        , (PROBE_CONVDUP == 2) && rep == 1
#endif
        );
#endif
}

__device__ __forceinline__ void phase_post(const Params& p, int l, int gw, int NGW, int lane) {
    const bf16* Z = (const bf16*)(p.ws + WS_Z); const float* GO = (const float*)(p.ws + WS_GO); const float* HO = (const float*)(p.ws + WS_HO); const float* HDEN = (const float*)(p.ws + WS_HDEN);
    bf16* BR2 = (bf16*)(p.ws + WS_BR) + 2 * BW; bf16* BR3 = (bf16*)(p.ws + WS_BR) + 3 * BW;
    const float* gng = p.in[I_GDNNG] + l * 128; const float* mng = p.in[I_MLNG] + l * BW;
    for (int t = gw; t < T; t += NGW) {
        {   const v4f a0 = *(const v4f*)(GO + (size_t)t * BW + 8 * lane), a1 = *(const v4f*)(GO + (size_t)t * BW + 8 * lane + 4); float o[8] = {a0.x, a0.y, a0.z, a0.w, a1.x, a1.y, a1.z, a1.w}; float ss = 0.f;
#pragma unroll
            for (int i = 0; i < 8; ++i) ss += o[i] * o[i];
            const float r = rsqrtf(sum16(ss) * (1.f / 128.f) + LN_EPS);
            const v4u graw = *(const v4u*)(Z + (size_t)t * ZC + ZC_GDNG + 8 * lane); float gt[8]; unpack8(graw, gt);
#pragma unroll
            for (int i = 0; i < 8; ++i) o[i] = o[i] * r * gng[(8 * lane + i) & 127] * siluf_(gt[i]);
#if MERGE_FP8
            *(v2u*)((unsigned char*)(p.ws + WS_BR) + (size_t)t * BRW + 2 * BW + 8 * lane) = (v2u){pk4_f8(o[0], o[1], o[2], o[3], BRSC), pk4_f8(o[4], o[5], o[6], o[7], BRSC)}; }
#else
            v4u w; w.x = pk2(o[0], o[1]); w.y = pk2(o[2], o[3]); w.z = pk2(o[4], o[5]); w.w = pk2(o[6], o[7]); *(v4u*)(BR2 + (size_t)t * BRW + 8 * lane) = w; }
#endif
        {   const v4f a0 = *(const v4f*)(HO + (size_t)t * BW + 8 * lane), a1 = *(const v4f*)(HO + (size_t)t * BW + 8 * lane + 4); float o[8] = {a0.x, a0.y, a0.z, a0.w, a1.x, a1.y, a1.z, a1.w}; float ss = 0.f;
            const float dn = 1.f / fmaxf(fabsf(HDEN[(size_t)t * 4 + (lane >> 4)]), 1.f);
#pragma unroll
            for (int i = 0; i < 8; ++i) { o[i] *= dn; ss += o[i] * o[i]; }
            const float r = rsqrtf(sum16(ss) * (1.f / 128.f) + LN_EPS);
            const v4u graw = *(const v4u*)(Z + (size_t)t * ZC + ZC_MLO + 8 * lane); float gt[8]; unpack8(graw, gt);
#pragma unroll
            for (int i = 0; i < 8; ++i) o[i] = o[i] * r * mng[8 * lane + i] * sigmoidf_(gt[i]);
#if MERGE_FP8
            *(v2u*)((unsigned char*)(p.ws + WS_BR) + (size_t)t * BRW + 3 * BW + 8 * lane) = (v2u){pk4_f8(o[0], o[1], o[2], o[3], BRSC), pk4_f8(o[4], o[5], o[6], o[7], BRSC)}; }
#else
            v4u w; w.x = pk2(o[0], o[1]); w.y = pk2(o[2], o[3]); w.z = pk2(o[4], o[5]); w.w = pk2(o[6], o[7]); *(v4u*)(BR3 + (size_t)t * BRW + 8 * lane) = w; }
#endif
    }
}

__device__ __forceinline__ void ln_row(const float* yrow, const float* g, const float* b, int lane, v4f (&v)[8]) {
    const v4f* yr = (const v4f*)yrow + lane; float s = 0.f;
#pragma unroll
    for (int j = 0; j < 8; ++j) { v[j] = yr[64 * j]; s += (v[j].x + v[j].y) + (v[j].z + v[j].w); }
    const float mean = wave_sum(s) * (1.f / D); float s2 = 0.f;
#pragma unroll
    for (int j = 0; j < 8; ++j) { v[j] = v[j] - mean; s2 += (v[j].x * v[j].x + v[j].y * v[j].y) + (v[j].z * v[j].z + v[j].w * v[j].w); }
    const float rstd = rsqrtf(wave_sum(s2) * (1.f / D) + LN_EPS);
#pragma unroll
    for (int j = 0; j < 8; ++j) { const v4f gg = ((const v4f*)g)[lane + 64 * j], bb = ((const v4f*)b)[lane + 64 * j]; v[j] = v[j] * rstd * gg + bb; }
}
constexpr int RT_XP = 2052;
constexpr int RT_TAB = 131072 + 1024;
__device__ __forceinline__ void phase_ln1_router(const Params& p, int l, LAS unsigned char* lds, int wg, int G, int wave, int lane, int cnt_shift = 0) {
    const bf16* Y = (const bf16*)(p.ws + WS_Y); bf16* X1 = (bf16*)(p.ws + WS_X1); bf16* X1B = (bf16*)(p.ws + WS_X1B); int* LIST = (int*)(p.ws + WS_LIST); float* WL = (float*)(p.ws + WS_WL); unsigned* SLOT = (unsigned*)(p.ws + WS_SLOT);
    unsigned* cnt = (unsigned*)(p.ws + WS_CTL) + CW_CNT + l * 4096 + cnt_shift;
    const float* g1 = p.in[I_LN1G] + (size_t)l * D; const float* b1 = p.in[I_LN1B] + (size_t)l * D;
    const float* wr = p.in[I_WR] + (size_t)l * D * NE; const float rbias = p.in[I_RB][l * NE + lane];
    LAS float* xt = (LAS float*)lds;
    LAS float* part = (LAS float*)lds;
    LAS unsigned char* selm = lds + RT_TAB; LAS unsigned char* rkm = selm + 4096; LAS float* wtm = (LAS float*)(rkm + 4096); LAS unsigned* basem = (LAS unsigned*)(wtm + 4096);
    const int n_l = lane & 15, kq = lane >> 4;
    int gi = 0;
    for (int tg = wg; tg < T / 16; tg += G, ++gi) {
        {   v4f va[8], vb[8]; const size_t m0 = (size_t)tg * 16 + 2 * wave;
#pragma unroll
            for (int j = 0; j < 8; ++j) { va[j] = ld4(Y, m0 * D + 4 * lane + 256 * j, true); vb[j] = ld4(Y, (m0 + 1) * D + 4 * lane + 256 * j, true); }
            float sa = 0.f, sb = 0.f;
#pragma unroll
            for (int j = 0; j < 8; ++j) { sa += (va[j].x + va[j].y) + (va[j].z + va[j].w); sb += (vb[j].x + vb[j].y) + (vb[j].z + vb[j].w); }
            const float ma = wave_sum(sa) * (1.f / D), mb = wave_sum(sb) * (1.f / D); float qa = 0.f, qb = 0.f;
#pragma unroll
            for (int j = 0; j < 8; ++j) { va[j] = va[j] - ma; vb[j] = vb[j] - mb; qa += (va[j].x * va[j].x + va[j].y * va[j].y) + (va[j].z * va[j].z + va[j].w * va[j].w); qb += (vb[j].x * vb[j].x + vb[j].y * vb[j].y) + (vb[j].z * vb[j].z + vb[j].w * vb[j].w); }
            const float ra = rsqrtf(wave_sum(qa) * (1.f / D) + LN_EPS), rb = rsqrtf(wave_sum(qb) * (1.f / D) + LN_EPS);
#pragma unroll
            for (int j = 0; j < 8; ++j) { const v4f gg = ((const v4f*)g1)[lane + 64 * j], bb = ((const v4f*)b1)[lane + 64 * j]; va[j] = va[j] * ra * gg + bb; vb[j] = vb[j] * rb * gg + bb; }
#pragma unroll
            for (int rr = 0; rr < 2; ++rr) { const size_t m = m0 + rr; v2u* xo = (v2u*)(X1 + m * D) + lane;
#pragma unroll
                for (int j = 0; j < 8; ++j) { const v4f v = rr ? vb[j] : va[j]; xo[64 * j] = (v2u){pk2(v.x, v.y), pk2(v.z, v.w)};
#if MOE_UP_FP8
                    { unsigned w = 0; w = __builtin_amdgcn_cvt_pk_fp8_f32(v.x, v.y, w, false); w = __builtin_amdgcn_cvt_pk_fp8_f32(v.z, v.w, w, true); ((unsigned*)((unsigned char*)X1B + m * D))[lane + 64 * j] = w; }
#else
                    { v2u o; o.x = pk2(v.x, v.y); o.y = pk2(v.z, v.w); ((v2u*)(X1B + m * D))[lane + 64 * j] = o; }
#endif
                    *(LAS v4f*)(xt + (2 * wave + rr) * RT_XP + 4 * lane + 256 * j) = v; } } }
        __syncthreads();
        {   pg8::f32x4 acc[4];
#pragma unroll
            for (int i = 0; i < 4; ++i) acc[i] = (pg8::f32x4){0.f, 0.f, 0.f, 0.f};
            const float* wb = wr + (size_t)(256 * wave + 4 * kq) * NE + 4 * n_l;
            const LAS float* xa = xt + n_l * RT_XP + 256 * wave + 4 * kq;
            v4f bwa[16], bwb[16];
#define RT_LOADW(dst, sb_) do { _Pragma("unroll") for (int q = 0; q < 16; ++q) dst[q] = *(const v4f*)(wb + (size_t)(16 * (4 * (sb_) + (q >> 2)) + (q & 3)) * NE); } while (0)
#define RT_MMA(src, sb_) do { _Pragma("unroll") for (int sg = 0; sg < 4; ++sg) { const v4f a4 = *(const LAS v4f*)(xa + 16 * (4 * (sb_) + sg)); \
                _Pragma("unroll") for (int c = 0; c < 4; ++c) { const v4f b4 = src[sg * 4 + c]; const float a = c == 0 ? a4.x : c == 1 ? a4.y : c == 2 ? a4.z : a4.w; \
                    acc[0] = __builtin_amdgcn_mfma_f32_16x16x4f32(a, b4.x, acc[0], 0, 0, 0); acc[1] = __builtin_amdgcn_mfma_f32_16x16x4f32(a, b4.y, acc[1], 0, 0, 0); \
                    acc[2] = __builtin_amdgcn_mfma_f32_16x16x4f32(a, b4.z, acc[2], 0, 0, 0); acc[3] = __builtin_amdgcn_mfma_f32_16x16x4f32(a, b4.w, acc[3], 0, 0, 0); } } } while (0)
            RT_LOADW(bwa, 0);
#pragma unroll 1
            for (int h = 0; h < 2; ++h) {
                RT_LOADW(bwb, 1); RT_MMA(bwa, 0);
                if (h == 0) RT_LOADW(bwa, 2);
                RT_MMA(bwb, 1);
                wb += (size_t)128 * NE; xa += 128; asm volatile("" : "+v"(wb));
            }
#undef RT_LOADW
#undef RT_MMA
            __syncthreads();
#pragma unroll
            for (int j = 0; j < 4; ++j) *(LAS v4f*)(part + (wave * 16 + 4 * kq + j) * 64 + 4 * n_l) = (v4f){acc[0][j], acc[1][j], acc[2][j], acc[3][j]}; }
        __syncthreads();
#pragma unroll 1
        for (int rr = 0; rr < 2; ++rr) { const int lr = wave + 8 * rr; float logit = 0.f;
#pragma unroll
            for (int w = 0; w < 8; ++w) logit += part[(w * 16 + lr) * 64 + lane];
            const float s = sigmoidf_(logit), biased = s + rbias;
            const float m1 = max8(biased); const float li = (float)(lane & 7);
            const float first = min8(biased == m1 ? li : 8.f);
            const float m2 = max8(li == first ? -INFINITY : biased);
            const float gs = m1 + m2; const int myg = lane >> 3; int grank = 0;
#pragma unroll
            for (int g2 = 0; g2 < 8; ++g2) { const float o = __builtin_bit_cast(float, __builtin_amdgcn_readlane(__builtin_bit_cast(int, gs), g2 * 8)); grank += (o > gs || (o == gs && g2 < myg)) ? 1 : 0; }
            const float masked = grank < 4 ? biased : -INFINITY; int rank = 0;
#pragma unroll
            for (int e2 = 0; e2 < 64; ++e2) { const float o = __builtin_bit_cast(float, __builtin_amdgcn_readlane(__builtin_bit_cast(int, masked), e2)); rank += (o > masked || (o == masked && e2 < lane)) ? 1 : 0; }
            const float wsel = rank < 6 ? s : 0.f; const float tot = wave_sum(wsel);
            const int ri = gi * 16 + lr;
            selm[ri * 64 + lane] = (rank < 6) ? 1 : 0; rkm[ri * 64 + lane] = (unsigned char)rank; wtm[ri * 64 + lane] = wsel / tot * 2.5f; }
        __syncthreads();
    }
    const int nrows = gi * 16;
    if (wave == 0) { unsigned n = 0;
        for (int r = 0; r < nrows; ++r) n += selm[r * 64 + lane];
        unsigned base = 0; if (n && !(PROBE_NOATOM && cnt_shift)) base = __hip_atomic_fetch_add(cnt + 64 * lane, n, __ATOMIC_RELAXED, __HIP_MEMORY_SCOPE_AGENT);
        basem[lane] = base; }
    __syncthreads();
    for (int ri = wave; ri < nrows; ri += 8) { unsigned pos = basem[lane];
        for (int r = 0; r < ri; ++r) pos += selm[r * 64 + lane];
        if (selm[ri * 64 + lane]) { const size_t m = (size_t)(wg + (ri >> 4) * G) * 16 + (ri & 15); const int rk = rkm[ri * 64 + lane];
            LIST[lane * T + pos] = (int)m; WL[lane * T + pos] = wtm[ri * 64 + lane]; SLOT[m * 8 + rk] = ((unsigned)lane << 16) | pos; } }
    __syncthreads();
}
__device__ __forceinline__ void phase_combine_ln2(const Params& p, int l, void* dst, bool dbf, int gw, int NGW, int lane) {
    const bf16* X1 = (const bf16*)(p.ws + WS_X1); const bf16* YE = (const bf16*)(p.ws + WS_YEXP); const unsigned* SLOT = (const unsigned*)(p.ws + WS_SLOT);
    const unsigned* cnt = (const unsigned*)(p.ws + WS_CTL) + CW_CNT + l * 4096;
    const float* g2 = p.in[I_LN2G] + (size_t)l * D; const float* b2 = p.in[I_LN2B] + (size_t)l * D;
    const int tiles = ((int)cnt[64 * lane] + 255) >> 8; const float incl = wave_scan_incl((float)tiles);
    const int toff = (int)incl - tiles;
    const int tsh = __builtin_amdgcn_readlane((int)incl, 63);
    for (int m = gw; m < T; m += NGW) {
        v4f v[8];
#pragma unroll
        for (int j = 0; j < 8; ++j) v[j] = ld4(X1, (size_t)m * D + 4 * lane + 256 * j, true) * ALPHA;
#pragma unroll
        for (int k = 0; k < 7; ++k) { size_t row;
            if (k == 0) row = (size_t)tsh * 256 + m;
            else { const unsigned s = __builtin_amdgcn_readfirstlane(SLOT[(size_t)m * 8 + (k - 1)]); const int e = (int)(s >> 16); row = (size_t)__builtin_amdgcn_readlane(toff, e) * 256 + (s & 0xffffu); }
            const v2u* yr = (const v2u*)(YE + row * D) + lane;
#pragma unroll
            for (int j = 0; j < 8; ++j) { const v2u y = yr[64 * j]; v[j].x += bflo(y.x); v[j].y += bfhi(y.x); v[j].z += bflo(y.y); v[j].w += bfhi(y.y); } }
        float s = 0.f;
#pragma unroll
        for (int j = 0; j < 8; ++j) s += (v[j].x + v[j].y) + (v[j].z + v[j].w);
        const float mean = wave_sum(s) * (1.f / D); float s2 = 0.f;
#pragma unroll
        for (int j = 0; j < 8; ++j) { v[j] = v[j] - mean; s2 += (v[j].x * v[j].x + v[j].y * v[j].y) + (v[j].z * v[j].z + v[j].w * v[j].w); }
        const float rstd = rsqrtf(wave_sum(s2) * (1.f / D) + LN_EPS);
#pragma unroll
        for (int j = 0; j < 8; ++j) { const v4f gg = ((const v4f*)g2)[lane + 64 * j], bb = ((const v4f*)b2)[lane + 64 * j]; const v4f o = v[j] * rstd * gg + bb;
            if (dbf) ((v2u*)((bf16*)dst + (size_t)m * D))[lane + 64 * j] = (v2u){pk2(o.x, o.y), pk2(o.z, o.w)};
            else ((v4f*)((float*)dst + (size_t)m * D))[lane + 64 * j] = o; }
    }
}

constexpr int NPH = 11;
template <class S> struct DupOrder {
    S s; int n;
    __device__ __forceinline__ bool next(int i, Unit& u) const { return s.next(i >= n ? i - n : i, u); }
    __device__ __forceinline__ int row_token(int i, int r) const { return s.row_token(i >= n ? i - n : i, r); }
    __device__ __forceinline__ void a_ready(const Unit& u) const { s.a_ready(u); }
    __device__ __forceinline__ void done(const Unit& u) const { s.done(u); }
};
template <class S> __device__ __forceinline__ int count_units(const S& s) { Unit u; int n = 0; while (n < 64 && s.next(n, u)) ++n; return n; }
#define ORDER_T(k, T) typename std::conditional<PROBE_DUP == (k), DupOrder<T>, T>::type
template <class S> __device__ __forceinline__ DupOrder<S> make_order(const S& s, std::true_type) { DupOrder<S> d{s, count_units(s)}; d.n = count_units(s); return d; }
template <class S> __device__ __forceinline__ S make_order(const S& s, std::false_type) { return s; }
#define MAKE_ORDER(k, s) make_order(s, std::integral_constant<bool, PROBE_DUP == (k)>())
template <int l>
__device__ __forceinline__ void run_layer(const Params& p, LAS unsigned char* lds, const XcdBarrier& bar, int tid, int lane, int wave, int G, int wg, int gw, int NGW) {
    unsigned char* ws = p.ws;
    {
        const void* xin = (l == 0) ? (const void*)p.in[I_X] : (const void*)(ws + WS_XCUR);
        void* xout = (l == NL - 1) ? (void*)p.out : (void*)(ws + WS_XCUR);
#ifndef PROBE_DUP
#define PROBE_DUP (-1)
#endif
#define IS_GEMM_PH(k) ((k) == 1 || (k) == 5 || (k) == 6 || (k) == 8 || (k) == 9)
#define REP(k) _Pragma("nounroll") for (int _r = 0; _r < ((PROBE_DUP == (k) && !IS_GEMM_PH(k)) ? 2 + (p.ph_lo >> 20) : 1); ++_r)
#ifndef PH_MASK
#define PH_MASK 0x7ff
#endif
#define RUN(k) (((PH_MASK >> (k)) & 1) && p.ph_lo <= l * NPH + (k) && l * NPH + (k) < p.ph_hi)
#define SEAM(k) do { if (l * NPH + (k) + 1 < p.ph_hi) xcd_barrier(bar); } while (0)
        if (RUN(0)) { REP(0) { phase_convert<0>(p, l, lds, gw, NGW, wave, lane);
#if defined(PROBE_CONV0)
            phase_convert<1>(p, l, lds, gw, NGW, wave, lane);
#endif
 phase_xprep(p, l, xin, l > 0, lds, gw, NGW, tid, lane); } SEAM(0); }
        if (RUN(1)) { REP(1) { pg8::Gemm g{(const bf16*)(ws + WS_XB), (const bf16*)(ws + WS_WIN), T, ZC, D / 2, D / 2, D / 2}; pg8::StaticOrder S; S.init(T, ZC, G, wg);
            pg8::EpiBf16<0> E{(bf16*)(ws + WS_Z), ZC, nullptr, 0, 0, 1.f / 64.f};
            auto S2 = MAKE_ORDER(1, S); pg8::gemm_phase<pg8::EpiBf16<0>, ORDER_T(1, pg8::StaticOrder), true, true, true>(lds, g, S2, E); } SEAM(1); }
        if (RUN(2)) { REP(2) { for (int it = wg; it < 1536; it += G) { if (it < 512) gdn_pre_item(p, l, lds, it, tid, wave, lane); else if (it < 1024) ml_pre_item(p, l, lds, it - 512, tid, wave, lane); else vt_item(p, lds, it - 1024, tid); } } SEAM(2); }
        if (RUN(3)) { REP(3) { phase_mixers(p, l, lds, wg, G, tid, wave, lane, bar); } SEAM(3); }
        if (RUN(4)) { REP(4) { phase_post(p, l, gw, NGW, lane); } SEAM(4); }
        if (RUN(5)) { REP(5) { constexpr int KM = MERGE_FP8 ? BRW / 2 : BRW; pg8::Gemm g{(const bf16*)(ws + WS_BR), (const bf16*)(ws + WS_WBR), T, D, KM, KM, KM}; pg8::StaticOrder S; S.init(T, D, G, wg);
            EpiMergeH E{(const bf16*)(ws + WS_Z), (bf16*)(ws + WS_MSUM)};
            auto S2 = MAKE_ORDER(5, S); pg8::gemm_phase<EpiMergeH, ORDER_T(5, pg8::StaticOrder), true, true, MERGE_FP8 != 0>(lds, g, S2, E); } SEAM(5); }
        if (RUN(6)) { REP(6) { pg8::Gemm g{(const bf16*)(ws + WS_MSUM), (const bf16*)(ws + WS_WOUT), T, D, D / 2, D / 2, D / 2}; pg8::StaticOrder S; S.init(T, D, G, wg);
            EpiResid E{xin, (bf16*)(ws + WS_Y), 1.f / 64.f, l > 0};
            auto S2 = MAKE_ORDER(6, S); pg8::gemm_phase<EpiResid, ORDER_T(6, pg8::StaticOrder), true, true, true>(lds, g, S2, E); } SEAM(6); }
        if (RUN(7)) { REP(7) { phase_ln1_router(p, l, lds, wg, G, wave, lane, (PROBE_DUP == 7 && _r == 0) ? 16384 : 0); } SEAM(7); }
        if (RUN(8)) { REP(8) { const unsigned* cnt = (const unsigned*)(ws + WS_CTL) + CW_CNT + l * 4096; MoeTab M(lds); moe_tables(M, cnt, tid, lane, wave);
            UpOrder S{M, 0}; S.n = up_order_build(M, (const int*)(ws + WS_LIST), (const float*)(ws + WS_WL), wg, G, tid);
            constexpr int KU = MOE_UP_FP8 ? D / 2 : D;
            pg8::Gemm g{(const bf16*)(ws + WS_X1B), (const bf16*)(ws + WS_WUP), T, NEX * 1024, KU, KU, KU};
            EpiGluSparse E{(LAS const float*)M.wt, (bf16*)(ws + WS_HB)};
            auto S2 = MAKE_ORDER(8, S); pg8::gemm_phase_gather<EpiGluSparse, ORDER_T(8, UpOrder), MOE_UP_FP8 != 0>(lds, g, S2, E); } SEAM(8); }
        if (RUN(9)) { REP(9) { const unsigned* cnt = (const unsigned*)(ws + WS_CTL) + CW_CNT + l * 4096; MoeTab M(lds); moe_tables(M, cnt, tid, lane, wave);
            DownOrder S{M, G, wg, 8 * M.t[65]};
            constexpr int KD = MOE_DN_FP8 ? ED / 2 : ED;
            pg8::Gemm g{(const bf16*)(ws + WS_HB), (const bf16*)(ws + WS_WDN), HROWS, NEX * D, KD, KD, KD};
            EpiYexp E{(bf16*)(ws + WS_YEXP)};
            auto S2 = MAKE_ORDER(9, S); pg8::gemm_phase<EpiYexp, ORDER_T(9, DownOrder), true, true, MOE_DN_FP8 != 0>(lds, g, S2, E); } SEAM(9); }
        if (RUN(10)) { REP(10) { phase_combine_ln2(p, l, xout, l != NL - 1, gw, NGW, lane); } SEAM(10); }
#undef RUN
#undef SEAM
    }
}
__global__ void __launch_bounds__(512, 2) fwd_kernel(Params p) {
    extern __shared__ __attribute__((aligned(16))) unsigned char lds_raw[];
    LAS unsigned char* lds = (LAS unsigned char*)lds_raw;
    const int tid = threadIdx.x, lane = tid & 63, wave = __builtin_amdgcn_readfirstlane(tid >> 6);
    const int G = gridDim.x, wg = blockIdx.x, gw = wg * 8 + wave, NGW = G * 8;
    volatile LAS unsigned* MISC = (volatile LAS unsigned*)(lds + MISC_OFF);
    if (tid < 32) MISC[tid] = 0u;
    __syncthreads();
    unsigned* ctl = (unsigned*)(p.ws + WS_CTL);
    const bool multi = (p.ph_hi - p.ph_lo) > 1;
    XcdBarrier bar; bar.bar = ctl + CW_BAR; bar.x = 0; bar.st = nullptr;
    if (multi) bar = xcd_barrier_post(ctl + CW_BAR, MISC + 8);
    run_layer<0>(p, lds, bar, tid, lane, wave, G, wg, gw, NGW);
    run_layer<1>(p, lds, bar, tid, lane, wave, G, wg, gw, NGW);
}

#ifndef MK_MULTI_LAUNCH
#define MK_MULTI_LAUNCH 0
#endif
extern "C" void kernel_launch(void* const* d_in, const int* in_sizes, int n_in, void* d_out, int out_size, void* d_ws, size_t ws_size, hipStream_t stream) {
    static int grid = 0;
    if (grid == 0) {
        if (n_in != 27 || out_size != T * D || ws_size < WS_END) { fprintf(stderr, "kernel_launch: unexpected shapes (n_in %d out %d ws %zu need %zu)\n", n_in, out_size, ws_size, (size_t)WS_END); grid = -1; return; }
        int dev = 0, cus = 0, per_cu = 0;
        if (hipGetDevice(&dev) != hipSuccess || hipDeviceGetAttribute(&cus, hipDeviceAttributeMultiprocessorCount, dev) != hipSuccess) { grid = -1; return; }
        if (hipFuncSetAttribute((const void*)fwd_kernel, hipFuncAttributeMaxDynamicSharedMemorySize, LDS_BYTES) != hipSuccess) { fprintf(stderr, "kernel_launch: hipFuncSetAttribute failed\n"); grid = -1; return; }
        if (hipOccupancyMaxActiveBlocksPerMultiprocessor(&per_cu, (const void*)fwd_kernel, 512, LDS_BYTES) != hipSuccess || per_cu < 1) { fprintf(stderr, "kernel_launch: occupancy query says %d\n", per_cu); }
        (void)hipGetLastError();
        grid = cus;
    }
    if (grid < 0) return;
    (void)hipMemsetAsync((char*)d_ws + WS_CTL, 0, CTL_ZERO_BYTES, stream);
    Params p{};
    for (int i = 0; i < 27; ++i) p.in[i] = (const float*)d_in[i];
    p.out = (float*)d_out; p.ws = (unsigned char*)d_ws;
#if MK_MULTI_LAUNCH
    for (int ph = 0; ph < NL * NPH; ++ph) { p.ph_lo = ph; p.ph_hi = ph + 1; hipLaunchKernelGGL(fwd_kernel, dim3(grid), dim3(512), LDS_BYTES, stream, p); }
#else
    p.ph_lo = 0; p.ph_hi = NL * NPH; hipLaunchKernelGGL(fwd_kernel, dim3(grid), dim3(512), LDS_BYTES, stream, p);
#endif
}
```

```cpp
#include <hip/hip_runtime.h>
#include <cstdio>
#include <cstdint>
#include <type_traits>
namespace pg8 {
#define PG8_LAS __attribute__((address_space(3)))
typedef unsigned short bf16_t;
typedef short bf16x8 __attribute__((ext_vector_type(8)));
typedef float f32x4 __attribute__((ext_vector_type(4)));
typedef unsigned u32x4 __attribute__((ext_vector_type(4)));
constexpr int BM = 256, BK = 64, HALF = 128, HTB = HALF * BK * 2  , STAGE_BYTES = 8 * HTB, NXCD = 8, WGM = 8;

__host__ __device__ __forceinline__ int lds_byte(int r, int c) { const int st = (r >> 4) * 2 + (c >> 5), rr = r & 15, cc = c & 31, ob = rr * 64 + cc * 2; return st * 1024 + (ob ^ (((ob >> 9) & 1) << 5)); }
__host__ __device__ __forceinline__ void stage_rc(int b, int& R, int& C) { const int st = b / 1024, sb = b % 1024, swz = sb ^ (((sb >> 9) & 1) << 5); R = (st >> 1) * 16 + swz / 64; C = (st & 1) * 32 + (swz % 64) / 2; }
__host__ __device__ __forceinline__ int perm32(int rho) { const int n = rho >> 4, i = rho & 15; return 8 * (i >> 2) + 4 * n + (i & 3); }

struct Unit { int pm, pn, aux; };
struct Gemm { const bf16_t* A; const bf16_t* Bt; int M, N, K, lda, ldb; };

struct StaticOrder {
    int nM, nN, nwg, G, c;
    __host__ __device__ void init(int M, int N, int G_, int c_) { nM = M / BM; nN = N / BM; nwg = nM * nN; G = G_; c = c_; }
    __host__ __device__ bool next(int i, Unit& u) const {
        const long L = (long)i * G + c; if (L >= nwg) return false;
        int wgid = (int)L; { const int q = nwg / NXCD, r = nwg % NXCD, xcd = wgid % NXCD, off = wgid / NXCD; wgid = (xcd < r ? xcd * (q + 1) : r * (q + 1) + (xcd - r) * q) + off; }
        const int nig = WGM * nN, gid = wgid / nig, fm = gid * WGM, gsz = (nM - fm) < WGM ? (nM - fm) : WGM;
        u.pm = fm + ((wgid % nig) % gsz); u.pn = (wgid % nig) / gsz; return true;
    }
    __device__ __forceinline__ void a_ready(const Unit&) const {}
    __device__ __forceinline__ void done(const Unit&) const {}
};

__device__ __forceinline__ unsigned cvt_pk_bf16(float lo, float hi) { unsigned r; asm volatile("v_cvt_pk_bf16_f32 %0, %1, %2" : "=v"(r) : "v"(lo), "v"(hi)); return r; }
typedef float f32x2 __attribute__((ext_vector_type(2)));
__device__ __forceinline__ f32x2 gelu_pk(f32x2 v) {
    const f32x2 av = __builtin_elementwise_abs(v), d = av * 0.2316418882f + 1.0f;
    f32x2 t; t.x = __builtin_amdgcn_rcpf(d.x); t.y = __builtin_amdgcn_rcpf(d.y);
    f32x2 q = t * 0.5307027145f + (-0.7265760135f); q = q * t + 0.7107068705f; q = q * t + (-0.142248368f); q = q * t + 0.127414796f; q = q * t;
    const f32x2 s = (v * v) * (-0.72134752044f);
    f32x2 e; e.x = __builtin_amdgcn_exp2f(s.x); e.y = __builtin_amdgcn_exp2f(s.y);
    const f32x2 m = v * (q * e), r = v - m;
    f32x2 o; o.x = v.x < 0.f ? m.x : r.x; o.y = v.y < 0.f ? m.y : r.y; return o;
}

template <int ACT  > struct EpiBf16 {
    static constexpr bool PERM = true, AFTER_DRAIN = false; static constexpr int MID = 0; static_assert(ACT == 0 || ACT == 1, "EpiBf16: ACT is 0 (none) or 1 (gelu_pk)");
    bf16_t* O; int ldc; const float* bias; int split_cols; size_t split_stride; float scale0;
    __device__ __forceinline__ void operator()(const f32x4 (&acc)[2][2][4][2], const Unit& u, int wr, int wc, int fr, int fq) const {
        const int row0 = u.pm * BM + wr * 64 + fr; int colt = u.pn * BM; bf16_t* base = O;
        float sc = scale0; if (split_cols) { const int t = colt / split_cols; base += (size_t)t * split_stride; colt -= t * split_cols; if (t != 0) sc = 1.f; }
        const int col0 = colt + wc * 32 + 8 * fq, bcol0 = u.pn * BM + wc * 32 + 8 * fq;
        f32x4 bv[2][2];
#pragma unroll
        for (int bj = 0; bj < 2; ++bj)
#pragma unroll
            for (int n = 0; n < 2; ++n) bv[bj][n] = bias ? *(const f32x4*)(bias + bcol0 + bj * HALF + 4 * n) : (f32x4){0.f, 0.f, 0.f, 0.f};
#pragma unroll
        for (int ai = 0; ai < 2; ++ai)
#pragma unroll
            for (int m = 0; m < 4; ++m) { bf16_t* rowp = base + (size_t)(row0 + ai * HALF + m * 16) * ldc + col0;
#pragma unroll
                for (int bj = 0; bj < 2; ++bj) { f32x4 v0 = acc[ai][bj][m][0] + bv[bj][0], v1 = acc[ai][bj][m][1] + bv[bj][1];
                    if (ACT == 1) { f32x2 a = gelu_pk((f32x2){v0[0], v0[1]}), b = gelu_pk((f32x2){v0[2], v0[3]}), c = gelu_pk((f32x2){v1[0], v1[1]}), d = gelu_pk((f32x2){v1[2], v1[3]});
                        v0 = (f32x4){a.x, a.y, b.x, b.y}; v1 = (f32x4){c.x, c.y, d.x, d.y}; }
                    v0 = v0 * sc; v1 = v1 * sc; u32x4 w; w.x = cvt_pk_bf16(v0[0], v0[1]); w.y = cvt_pk_bf16(v0[2], v0[3]); w.z = cvt_pk_bf16(v1[0], v1[1]); w.w = cvt_pk_bf16(v1[2], v1[3]);
                    *(u32x4*)(rowp + bj * HALF) = w; } }
    }
};

typedef int i32x8 __attribute__((ext_vector_type(8)));
__device__ __forceinline__ i32x8 cat8(const bf16x8 a, const bf16x8 b) { typedef int i32x4 __attribute__((ext_vector_type(4))); const i32x4 x = __builtin_bit_cast(i32x4, a), y = __builtin_bit_cast(i32x4, b); return (i32x8){x[0], x[1], x[2], x[3], y[0], y[1], y[2], y[3]}; }
__device__ __forceinline__ bf16x8 lo8(const i32x8 v) { typedef int i32x4 __attribute__((ext_vector_type(4))); return __builtin_bit_cast(bf16x8, __builtin_shufflevector(v, v, 0, 1, 2, 3)); }
__device__ __forceinline__ bf16x8 hi8(const i32x8 v) { typedef int i32x4 __attribute__((ext_vector_type(4))); return __builtin_bit_cast(bf16x8, __builtin_shufflevector(v, v, 4, 5, 6, 7)); }
template <class Epi, class Sched, bool ALIGN_EPI = false, bool SP2 = false, bool FP8 = false>
__device__ __forceinline__ void gemm_phase(PG8_LAS unsigned char* lds, const Gemm g, const Sched& S, const Epi& E) {
    const int tid = threadIdx.x, wid = __builtin_amdgcn_readfirstlane(tid >> 6), lane = tid & 63, wr = wid >> 2, wc = wid & 3, fr = lane & 15, fq = lane >> 4;
    const int K = g.K, nt = K / BK;
    unsigned voffA[2], voffB[2];
#pragma unroll
    for (int i = 0; i < 2; ++i) { int R, C; stage_rc(tid * 16 + i * 8192, R, C); const int Rb = Epi::PERM ? ((R & ~31) + perm32(R & 31)) : R;
        voffA[i] = (unsigned)(R * g.lda + C) * 2u; voffB[i] = (unsigned)(Rb * g.ldb + C) * 2u; }
    const size_t kstep = (size_t)(BK * 2);
    const size_t hstepA = (size_t)HALF * g.lda * 2, hstepB = (size_t)HALF * g.ldb * 2;
    const size_t tstepA = 2 * hstepA, tstepB = 2 * hstepB;
    const unsigned ldsw = (unsigned)wid * 1024u;
    const int aoff = lds_byte(wr * 64 + fr, fq * 8), boff = lds_byte(wc * 32 + fr, fq * 8);
#define PG8_SA(b, h) (((b) * 2 + (h)) * HTB)
#define PG8_SB(b, h) ((4 + (b) * 2 + (h)) * HTB)
#define PG8_STAGE(bufoff, gbase, voff) do { _Pragma("unroll") for (int _i = 0; _i < 2; ++_i) \
        __builtin_amdgcn_global_load_lds((const unsigned*)((const char*)(gbase) + (voff)[_i]), (PG8_LAS unsigned*)(lds + (bufoff) + ldsw + _i * 8192), 16, 0, 0); } while (0)
#define PG8_LDA(dst, b, h) do { _Pragma("unroll") for (int m = 0; m < 4; ++m) { if constexpr (FP8) dst##8[m] = cat8(*(const PG8_LAS bf16x8*)(lds + PG8_SA(b, h) + aoff + m * 2048), *(const PG8_LAS bf16x8*)(lds + PG8_SA(b, h) + aoff + m * 2048 + 1024)); \
        else { _Pragma("unroll") for (int k = 0; k < 2; ++k) dst[m][k] = *(const PG8_LAS bf16x8*)(lds + PG8_SA(b, h) + aoff + m * 2048 + k * 1024); } } } while (0)
#define PG8_LDB(dst, b, h) do { _Pragma("unroll") for (int n = 0; n < 2; ++n) { if constexpr (FP8) dst##8[n] = cat8(*(const PG8_LAS bf16x8*)(lds + PG8_SB(b, h) + boff + n * 2048), *(const PG8_LAS bf16x8*)(lds + PG8_SB(b, h) + boff + n * 2048 + 1024)); \
        else { _Pragma("unroll") for (int k = 0; k < 2; ++k) dst[n][k] = *(const PG8_LAS bf16x8*)(lds + PG8_SB(b, h) + boff + n * 2048 + k * 1024); } } } while (0)
#define PG8_MMA(ai, bj, At, Bt) do { __builtin_amdgcn_s_setprio(1); _Pragma("unroll") for (int m = 0; m < 4; ++m) _Pragma("unroll") for (int n = 0; n < 2; ++n) { \
        if constexpr (FP8) asm volatile("v_mfma_scale_f32_16x16x128_f8f6f4 %0, %1, %2, %0, %3, %3 op_sel_hi:[0,0,0]" : "+v"(acc[ai][bj][m][n]) : "v"(Bt##8[n]), "v"(At##8[m]), "v"(fp8_unit_scale)); \
        else { _Pragma("unroll") for (int k = 0; k < 2; ++k) acc[ai][bj][m][n] = __builtin_amdgcn_mfma_f32_16x16x32_bf16(Bt[n][k], At[m][k], acc[ai][bj][m][n], 0, 0, 0); } } __builtin_amdgcn_s_setprio(0); } while (0)
#define PG8_WAIT_V(n) asm volatile("s_waitcnt vmcnt(" #n ")" ::: "memory")
#define PG8_WAIT_L(n) asm volatile("s_waitcnt lgkmcnt(" #n ")" ::: "memory")
#define PG8_BAR __builtin_amdgcn_s_barrier()
#define PG8_SCHED __builtin_amdgcn_sched_barrier(0)
    Unit cur, nxt; int ui = 0;
    if (!S.next(0, cur)) return;
    f32x4 acc[2][2][4][2];
#pragma unroll
    for (int a = 0; a < 2; ++a)
#pragma unroll
        for (int b = 0; b < 2; ++b)
#pragma unroll
            for (int m = 0; m < 4; ++m)
#pragma unroll
                for (int n = 0; n < 2; ++n) acc[a][b][m][n] = (f32x4){0.f, 0.f, 0.f, 0.f};
    int fp8_unit_scale = 0x7F7F7F7F; asm volatile("" : "+v"(fp8_unit_scale));
    bf16x8 At[4][2], B0[2][2], B1[2][2];
    i32x8 At8[4], B08[2], B18[2];
    const char* cA = (const char*)g.A + (size_t)cur.pm * tstepA; const char* cB = (const char*)g.Bt + (size_t)cur.pn * tstepB;
    S.a_ready(cur);
    if constexpr (SP2) {
        PG8_STAGE(PG8_SB(0, 0), cB, voffB); PG8_STAGE(PG8_SB(0, 1), cB + hstepB, voffB); PG8_STAGE(PG8_SA(0, 0), cA, voffA); PG8_STAGE(PG8_SA(0, 1), cA + hstepA, voffA);
        if (wr == 1) PG8_BAR;
        PG8_WAIT_V(2); PG8_BAR;
        PG8_STAGE(PG8_SB(1, 0), cB + kstep, voffB); PG8_STAGE(PG8_SA(1, 0), cA + kstep, voffA); PG8_STAGE(PG8_SB(1, 1), cB + hstepB + kstep, voffB);
        PG8_WAIT_V(6); PG8_BAR;
    } else {
        PG8_STAGE(PG8_SB(0, 0), cB, voffB); PG8_STAGE(PG8_SA(0, 0), cA, voffA); PG8_STAGE(PG8_SB(0, 1), cB + hstepB, voffB); PG8_STAGE(PG8_SA(0, 1), cA + hstepA, voffA);
        if (wr == 1) PG8_BAR;
        PG8_WAIT_V(4); PG8_BAR;
        PG8_STAGE(PG8_SB(1, 0), cB + kstep, voffB); PG8_STAGE(PG8_SA(1, 0), cA + kstep, voffA); PG8_STAGE(PG8_SB(1, 1), cB + hstepB + kstep, voffB);
        PG8_WAIT_V(6); PG8_BAR;
    }
    for (;;) {
        const bool has_next = S.next(ui + 1, nxt);
        const char* nA = has_next ? (const char*)g.A + (size_t)nxt.pm * tstepA : cA; const char* nB = has_next ? (const char*)g.Bt + (size_t)nxt.pn * tstepB : cB;
        for (int t = 0; t < nt; t += 2) {
            const bool last = (t == nt - 2);
            const char* a1 = cA + (size_t)(t + 1) * kstep;
            const char* a2 = last ? nA : cA + (size_t)(t + 2) * kstep; const char* b2 = last ? nB : cB + (size_t)(t + 2) * kstep;
            const char* a3 = a2 + kstep; const char* b3 = b2 + kstep;
            if (last && has_next) S.a_ready(nxt);
            if constexpr (SP2) {
            if constexpr (Epi::MID > 0) { if (t != 0 && (t % Epi::MID) == 0) { PG8_SCHED; if constexpr (FP8) asm volatile("s_nop 7\n\ts_nop 7" ::: "memory"); E.mid(acc, cur, t / Epi::MID, wr, wc, fr, fq); if constexpr (FP8) asm volatile("s_nop 7" ::: "memory"); PG8_SCHED; } }
            PG8_LDB(B0, 0, 0); PG8_LDB(B1, 0, 1); PG8_SCHED; PG8_LDA(At, 0, 0); PG8_STAGE(PG8_SA(1, 1), a1 + hstepA, voffA);
            PG8_WAIT_V(8); PG8_WAIT_L(0); PG8_BAR; PG8_MMA(0, 0, At, B0); PG8_MMA(0, 1, At, B1); PG8_BAR; PG8_SCHED;
            PG8_LDA(At, 0, 1); PG8_STAGE(PG8_SB(0, 0), b2, voffB); PG8_STAGE(PG8_SB(0, 1), b2 + hstepB, voffB); PG8_STAGE(PG8_SA(0, 0), a2, voffA);
            PG8_WAIT_V(8); PG8_WAIT_L(0); PG8_BAR; PG8_MMA(1, 0, At, B0); PG8_MMA(1, 1, At, B1); PG8_BAR; PG8_SCHED;
            PG8_LDB(B0, 1, 0); PG8_LDB(B1, 1, 1); PG8_SCHED; PG8_LDA(At, 1, 0); PG8_STAGE(PG8_SA(0, 1), a2 + hstepA, voffA);
            PG8_WAIT_V(8); PG8_WAIT_L(0); PG8_BAR; PG8_MMA(0, 0, At, B0); PG8_MMA(0, 1, At, B1); PG8_BAR; PG8_SCHED;
            PG8_LDA(At, 1, 1); PG8_STAGE(PG8_SB(1, 0), b3, voffB); PG8_STAGE(PG8_SB(1, 1), b3 + hstepB, voffB); PG8_STAGE(PG8_SA(1, 0), a3, voffA);
            PG8_WAIT_V(8); PG8_WAIT_L(0); PG8_BAR; PG8_MMA(1, 0, At, B0); PG8_MMA(1, 1, At, B1); PG8_BAR; PG8_SCHED;
            } else {
            PG8_LDB(B0, 0, 0); PG8_SCHED; PG8_LDA(At, 0, 0); PG8_STAGE(PG8_SA(1, 1), a1 + hstepA, voffA);
            PG8_WAIT_L(8); PG8_BAR; PG8_WAIT_L(0); PG8_MMA(0, 0, At, B0); PG8_BAR; PG8_SCHED;
            PG8_LDB(B1, 0, 1); PG8_STAGE(PG8_SB(0, 0), b2, voffB);
            PG8_BAR; PG8_WAIT_L(0); PG8_MMA(0, 1, At, B1); PG8_BAR;
            PG8_LDA(At, 0, 1); PG8_STAGE(PG8_SA(0, 0), a2, voffA);
            PG8_BAR; PG8_WAIT_L(0); PG8_MMA(1, 0, At, B0); PG8_BAR; PG8_SCHED;
            PG8_STAGE(PG8_SB(0, 1), b2 + hstepB, voffB);
            PG8_WAIT_V(6); PG8_BAR; PG8_MMA(1, 1, At, B1); PG8_BAR;
            PG8_LDB(B0, 1, 0); PG8_SCHED; PG8_LDA(At, 1, 0); PG8_STAGE(PG8_SA(0, 1), a2 + hstepA, voffA);
            PG8_WAIT_L(8); PG8_BAR; PG8_WAIT_L(0); PG8_MMA(0, 0, At, B0); PG8_BAR; PG8_SCHED;
            PG8_LDB(B1, 1, 1); PG8_STAGE(PG8_SB(1, 0), b3, voffB);
            PG8_BAR; PG8_WAIT_L(0); PG8_MMA(0, 1, At, B1); PG8_BAR;
            PG8_LDA(At, 1, 1); PG8_STAGE(PG8_SA(1, 0), a3, voffA);
            PG8_BAR; PG8_WAIT_L(0); PG8_MMA(1, 0, At, B0); PG8_BAR; PG8_SCHED;
            PG8_STAGE(PG8_SB(1, 1), b3 + hstepB, voffB);
            PG8_WAIT_V(6); PG8_BAR; PG8_MMA(1, 1, At, B1); PG8_BAR;
            }
        }
        if constexpr (ALIGN_EPI) { if (wr == 0) PG8_BAR; }
        if constexpr (FP8) asm volatile("s_nop 7\n\ts_nop 7" ::: "memory");
        if constexpr (!Epi::AFTER_DRAIN) { E(acc, cur, wr, wc, fr, fq); S.done(cur); }
        if (!has_next) break;
#pragma unroll
        for (int a = 0; a < 2; ++a)
#pragma unroll
            for (int b = 0; b < 2; ++b)
#pragma unroll
                for (int m = 0; m < 4; ++m)
#pragma unroll
                    for (int n = 0; n < 2; ++n) acc[a][b][m][n] = (f32x4){0.f, 0.f, 0.f, 0.f};
        cur = nxt; cA = nA; cB = nB; ++ui;
        if constexpr (ALIGN_EPI) { if (wr == 1) PG8_BAR; }
    }
    PG8_WAIT_V(0);
    if constexpr (!ALIGN_EPI) { if (wr == 0) PG8_BAR; }
    PG8_BAR;
    if constexpr (Epi::AFTER_DRAIN) { E.fused(acc, cur, wr, wc, fr, fq, lds, wid, lane); S.done(cur); }
#undef PG8_SA
#undef PG8_SB
#undef PG8_STAGE
#undef PG8_LDA
#undef PG8_LDB
#undef PG8_MMA
#undef PG8_WAIT_V
#undef PG8_WAIT_L
#undef PG8_BAR
#undef PG8_SCHED
}
template <class Epi, class Sched, bool FP8 = false>
__device__ __forceinline__ void gemm_phase_gather(PG8_LAS unsigned char* lds, const Gemm g, const Sched& S, const Epi& E) {
    const int tid = threadIdx.x, wid = __builtin_amdgcn_readfirstlane(tid >> 6), lane = tid & 63, wr = wid >> 2, wc = wid & 3, fr = lane & 15, fq = lane >> 4;
    const int K = g.K, nt = K / BK;
    unsigned voffB[2]; int RA[2], CA[2];
#pragma unroll
    for (int i = 0; i < 2; ++i) { int R, C; stage_rc(tid * 16 + i * 8192, R, C); const int Rb = Epi::PERM ? ((R & ~31) + perm32(R & 31)) : R;
        RA[i] = R; CA[i] = C; voffB[i] = (unsigned)(Rb * g.ldb + C) * 2u; }
    const size_t kstep = (size_t)(BK * 2);
    const size_t hstepB = (size_t)HALF * g.ldb * 2, tstepB = 2 * hstepB;
    const unsigned ldsw = (unsigned)wid * 1024u;
    const int aoff = lds_byte(wr * 64 + fr, fq * 8), boff = lds_byte(wc * 32 + fr, fq * 8);
#define PG8_SA(b, h) (((b) * 2 + (h)) * HTB)
#define PG8_SB(b, h) ((4 + (b) * 2 + (h)) * HTB)
#define PG8_STAGE(bufoff, gbase, voff) do { _Pragma("unroll") for (int _i = 0; _i < 2; ++_i) \
        __builtin_amdgcn_global_load_lds((const unsigned*)((const char*)(gbase) + (voff)[_i]), (PG8_LAS unsigned*)(lds + (bufoff) + ldsw + _i * 8192), 16, 0, 0); } while (0)
#define PG8_LDA(dst, b, h) do { _Pragma("unroll") for (int m = 0; m < 4; ++m) { if constexpr (FP8) dst##8[m] = cat8(*(const PG8_LAS bf16x8*)(lds + PG8_SA(b, h) + aoff + m * 2048), *(const PG8_LAS bf16x8*)(lds + PG8_SA(b, h) + aoff + m * 2048 + 1024)); \
        else { _Pragma("unroll") for (int k = 0; k < 2; ++k) dst[m][k] = *(const PG8_LAS bf16x8*)(lds + PG8_SA(b, h) + aoff + m * 2048 + k * 1024); } } } while (0)
#define PG8_LDB(dst, b, h) do { _Pragma("unroll") for (int n = 0; n < 2; ++n) { if constexpr (FP8) dst##8[n] = cat8(*(const PG8_LAS bf16x8*)(lds + PG8_SB(b, h) + boff + n * 2048), *(const PG8_LAS bf16x8*)(lds + PG8_SB(b, h) + boff + n * 2048 + 1024)); \
        else { _Pragma("unroll") for (int k = 0; k < 2; ++k) dst[n][k] = *(const PG8_LAS bf16x8*)(lds + PG8_SB(b, h) + boff + n * 2048 + k * 1024); } } } while (0)
#define PG8_MMA(ai, bj, At, Bt) do { __builtin_amdgcn_s_setprio(1); _Pragma("unroll") for (int m = 0; m < 4; ++m) _Pragma("unroll") for (int n = 0; n < 2; ++n) { \
        if constexpr (FP8) asm volatile("v_mfma_scale_f32_16x16x128_f8f6f4 %0, %1, %2, %0, %3, %3 op_sel_hi:[0,0,0]" : "+v"(acc[ai][bj][m][n]) : "v"(Bt##8[n]), "v"(At##8[m]), "v"(fp8_unit_scale)); \
        else { _Pragma("unroll") for (int k = 0; k < 2; ++k) acc[ai][bj][m][n] = __builtin_amdgcn_mfma_f32_16x16x32_bf16(Bt[n][k], At[m][k], acc[ai][bj][m][n], 0, 0, 0); } } __builtin_amdgcn_s_setprio(0); } while (0)
#define PG8_WAIT_V(n) asm volatile("s_waitcnt vmcnt(" #n ")" ::: "memory")
#define PG8_WAIT_L(n) asm volatile("s_waitcnt lgkmcnt(" #n ")" ::: "memory")
#define PG8_BAR __builtin_amdgcn_s_barrier()
#define PG8_SCHED __builtin_amdgcn_sched_barrier(0)
#define PG8_ROWS(dst, ui_) do { _Pragma("unroll") for (int _h = 0; _h < 2; ++_h) _Pragma("unroll") for (int _i = 0; _i < 2; ++_i) \
        dst[_h][_i] = (unsigned)S.row_token((ui_), _h * HALF + RA[_i]) * (unsigned)(g.lda * 2) + (unsigned)(CA[_i] * 2); } while (0)
    Unit cur, nxt; int ui = 0;
    if (!S.next(0, cur)) return;
    f32x4 acc[2][2][4][2];
#pragma unroll
    for (int a = 0; a < 2; ++a)
#pragma unroll
        for (int b = 0; b < 2; ++b)
#pragma unroll
            for (int m = 0; m < 4; ++m)
#pragma unroll
                for (int n = 0; n < 2; ++n) acc[a][b][m][n] = (f32x4){0.f, 0.f, 0.f, 0.f};
    int fp8_unit_scale = 0x7F7F7F7F; asm volatile("" : "+v"(fp8_unit_scale));
    bf16x8 At[4][2], B0[2][2], B1[2][2];
    i32x8 At8[4], B08[2], B18[2];
    unsigned offC[2][2];
    PG8_ROWS(offC, 0);
    const char* gA = (const char*)g.A;
    const char* cB = (const char*)g.Bt + (size_t)cur.pn * tstepB;
    PG8_STAGE(PG8_SB(0, 0), cB, voffB); PG8_STAGE(PG8_SB(0, 1), cB + hstepB, voffB); PG8_STAGE(PG8_SA(0, 0), gA, offC[0]); PG8_STAGE(PG8_SA(0, 1), gA, offC[1]);
    if (wr == 1) PG8_BAR;
    PG8_WAIT_V(2); PG8_BAR;
    PG8_STAGE(PG8_SB(1, 0), cB + kstep, voffB); PG8_STAGE(PG8_SA(1, 0), gA + kstep, offC[0]); PG8_STAGE(PG8_SB(1, 1), cB + hstepB + kstep, voffB);
    PG8_WAIT_V(6); PG8_BAR;
    for (;;) {
        const bool has_next = S.next(ui + 1, nxt);
        const char* nB = has_next ? (const char*)g.Bt + (size_t)nxt.pn * tstepB : cB;
        for (int t = 0; t < nt; t += 2) {
            const bool last = (t == nt - 2);
            const char* a1 = gA + (size_t)(t + 1) * kstep;
            const char* a2 = last ? gA : gA + (size_t)(t + 2) * kstep; const char* b2 = last ? nB : cB + (size_t)(t + 2) * kstep;
            const char* a3 = a2 + kstep; const char* b3 = b2 + kstep;
            PG8_LDB(B0, 0, 0); PG8_LDB(B1, 0, 1); PG8_SCHED; PG8_LDA(At, 0, 0); PG8_STAGE(PG8_SA(1, 1), a1, offC[1]);
            if (last && has_next) { PG8_ROWS(offC, ui + 1); }
            PG8_WAIT_V(8); PG8_WAIT_L(0); PG8_BAR; PG8_MMA(0, 0, At, B0); PG8_MMA(0, 1, At, B1); PG8_BAR; PG8_SCHED;
            PG8_LDA(At, 0, 1); PG8_STAGE(PG8_SB(0, 0), b2, voffB); PG8_STAGE(PG8_SB(0, 1), b2 + hstepB, voffB); PG8_STAGE(PG8_SA(0, 0), a2, offC[0]);
            PG8_WAIT_V(8); PG8_WAIT_L(0); PG8_BAR; PG8_MMA(1, 0, At, B0); PG8_MMA(1, 1, At, B1); PG8_BAR; PG8_SCHED;
            PG8_LDB(B0, 1, 0); PG8_LDB(B1, 1, 1); PG8_SCHED; PG8_LDA(At, 1, 0); PG8_STAGE(PG8_SA(0, 1), a2, offC[1]);
            PG8_WAIT_V(8); PG8_WAIT_L(0); PG8_BAR; PG8_MMA(0, 0, At, B0); PG8_MMA(0, 1, At, B1); PG8_BAR; PG8_SCHED;
            PG8_LDA(At, 1, 1); PG8_STAGE(PG8_SB(1, 0), b3, voffB); PG8_STAGE(PG8_SB(1, 1), b3 + hstepB, voffB); PG8_STAGE(PG8_SA(1, 0), a3, offC[0]);
            PG8_WAIT_V(8); PG8_WAIT_L(0); PG8_BAR; PG8_MMA(1, 0, At, B0); PG8_MMA(1, 1, At, B1); PG8_BAR; PG8_SCHED;
        }
        if (wr == 0) PG8_BAR;
        if constexpr (FP8) asm volatile("s_nop 7\n\ts_nop 7" ::: "memory");
        E(acc, cur, wr, wc, fr, fq); S.done(cur);
        if (!has_next) break;
#pragma unroll
        for (int a = 0; a < 2; ++a)
#pragma unroll
            for (int b = 0; b < 2; ++b)
#pragma unroll
                for (int m = 0; m < 4; ++m)
#pragma unroll
                    for (int n = 0; n < 2; ++n) acc[a][b][m][n] = (f32x4){0.f, 0.f, 0.f, 0.f};
        cur = nxt; cB = nB; ++ui;
        if (wr == 1) PG8_BAR;
    }
    PG8_WAIT_V(0);
    PG8_BAR;
#undef PG8_ROWS
#undef PG8_SA
#undef PG8_SB
#undef PG8_STAGE
#undef PG8_LDA
#undef PG8_LDB
#undef PG8_MMA
#undef PG8_WAIT_V
#undef PG8_WAIT_L
#undef PG8_BAR
#undef PG8_SCHED
}
}

#ifndef CONV_SKIP
#define CONV_SKIP 6
#endif
#ifndef MERGE_FP8
#define MERGE_FP8 1
#endif
#ifndef MOE_DN_FP8
#define MOE_DN_FP8 1
#endif
#ifndef MOE_UP_FP8
#define MOE_UP_FP8 1
#endif
#ifndef PROBE_NOATOM
#define PROBE_NOATOM 0
#endif
constexpr int T = 8192, D = 2048, NL = 2, BW = 512, ZC = 14336, INC = 14352;
constexpr int NE = 64, NEX = 65  , ED = 512;
constexpr int BRW = 4 * BW;
constexpr int HK = NEX * ED;
constexpr float ALPHA = 1.41421356237f;
constexpr float LN_EPS = 1e-5f;
constexpr float UPSC = MOE_UP_FP8 ? (1.f / 64.f) : 1.f;
constexpr float BRSC = MERGE_FP8 ? 8.f : 1.f, MGSC = MERGE_FP8 ? (1.f / (8.f * 64.f)) : 1.f;
constexpr float HSC = 8.f, DNSC = MOE_DN_FP8 ? (1.f / (HSC * 64.f)) : 1.f;
constexpr int ZC_SBQ = 0, ZC_SBK = 512, ZC_SBV = 1024, ZC_GMU = 1536, ZC_GMV = 2048, ZC_GDN = 2560, ZC_GDNG = 4096,
              ZC_MLQ = 4608, ZC_MLK = 4864, ZC_MLV = 5120, ZC_MLO = 5632, ZC_GATE = 6144;

#define GAS __attribute__((address_space(1)))
#define LAS __attribute__((address_space(3)))
typedef unsigned short bf16;
typedef unsigned v4u __attribute__((ext_vector_type(4)));
typedef unsigned v2u __attribute__((ext_vector_type(2)));
typedef float v4f __attribute__((ext_vector_type(4)));
typedef float v2f __attribute__((ext_vector_type(2)));
#define LDS_WAIT() asm volatile("s_waitcnt lgkmcnt(0)" ::: "memory")
#define LDS_BAR() do { asm volatile("s_waitcnt lgkmcnt(0)" ::: "memory"); __builtin_amdgcn_s_barrier(); asm volatile("" ::: "memory"); } while (0)

constexpr size_t MiB = 1u << 20;
constexpr size_t WS_CTL = 0, CTL_ZERO_BYTES = 1 * MiB;
constexpr size_t WS_WIN = 2 * MiB, WS_WBR = 58 * MiB, WS_WOUT = 66 * MiB, WS_WUP = 74 * MiB, WS_WDN = 334 * MiB;
constexpr size_t WS_XB = 464 * MiB, WS_SMALL = 496 * MiB, WS_EG = 497 * MiB, WS_BETA = WS_EG + 256 * 1024, WS_COMB = 498 * MiB;
constexpr size_t WS_Z = 500 * MiB, WS_GQ = 724 * MiB, WS_GK = 740 * MiB, WS_GV = 756 * MiB, WS_GO = 772 * MiB, WS_HO = 788 * MiB;
constexpr size_t WS_BR = 804 * MiB, WS_MTMP = 836 * MiB, WS_MSUM = 900 * MiB, WS_Y = 932 * MiB, WS_X1 = 996 * MiB, WS_X1B = 1060 * MiB;
constexpr size_t WS_XCUR = 1092 * MiB, WS_HB = 1156 * MiB, WS_YEXP = 1236 * MiB, WS_LIST = 1524 * MiB, WS_WL = 1526 * MiB, WS_SLOT = 1528 * MiB, WS_MQ = 1530 * MiB, WS_MS = 1534 * MiB, WS_MK = 1538 * MiB, WS_MV = 1542 * MiB, WS_MFL = 1552 * MiB, WS_HDEN = WS_MFL + 65536, WS_VT = 1553 * MiB, WS_END = 1561 * MiB;
constexpr size_t WS_GU = WS_GQ, WS_GNW = WS_GK, WS_GQG = WS_GK + 8 * MiB, WS_GKT = WS_GV, WS_GAT = WS_GV + 8 * MiB, WS_GDL = WS_GV + 12 * MiB;
constexpr int HROWS = 73728;
static_assert(WS_HB + (size_t)HROWS * ED * 2 <= WS_YEXP && WS_YEXP + (size_t)HROWS * D * 2 <= WS_LIST, "ws map (moe)");
static_assert(WS_WIN + (size_t)ZC * D * 2 <= WS_WBR && WS_WUP + (size_t)NEX * 1024 * D * 2 <= WS_WDN && WS_WDN + (size_t)D * HK * 2 <= WS_XB, "ws map (weights)");
static_assert(WS_Z + (size_t)T * ZC * 2 <= WS_GQ, "ws map (acts)");
constexpr int CW_BAR = 4096, CW_CNT = 16384;
constexpr int TAB_OFF = 131072 + 1024;
constexpr int LDS_BYTES = 163840, MISC_OFF = 131072 + 320;

__device__ __forceinline__ float bflo(unsigned w) { return __uint_as_float(w << 16); }
__device__ __forceinline__ float bfhi(unsigned w) { return __uint_as_float(w & 0xffff0000u); }
__device__ __forceinline__ unsigned f2bf(float f) { unsigned u = __float_as_uint(f); return (u + 0x7fffu + ((u >> 16) & 1u)) >> 16; }
__device__ __forceinline__ unsigned pk2(float lo, float hi) { return f2bf(lo) | (f2bf(hi) << 16); }
__device__ __forceinline__ unsigned pk4_f8(float a, float b, float c, float d, float sc) {
    a = __builtin_amdgcn_fmed3f(a * sc, -448.f, 448.f); b = __builtin_amdgcn_fmed3f(b * sc, -448.f, 448.f); c = __builtin_amdgcn_fmed3f(c * sc, -448.f, 448.f); d = __builtin_amdgcn_fmed3f(d * sc, -448.f, 448.f);
    unsigned w = 0; w = __builtin_amdgcn_cvt_pk_fp8_f32(a, b, w, false); w = __builtin_amdgcn_cvt_pk_fp8_f32(c, d, w, true); return w; }
__device__ __forceinline__ v4f ld4(const void* base, size_t idx, bool is_bf16) {
    if (is_bf16) { const v2u r = *(const v2u*)((const unsigned short*)base + idx); return (v4f){bflo(r.x), bfhi(r.x), bflo(r.y), bfhi(r.y)}; }
    return *(const v4f*)((const float*)base + idx); }
template <int CTRL> __device__ __forceinline__ float dpp(float x) { return __builtin_bit_cast(float, __builtin_amdgcn_mov_dpp(__builtin_bit_cast(int, x), CTRL, 0xf, 0xf, true)); }
__device__ __forceinline__ float sum4(float x) { x += dpp<0xB1>(x); x += dpp<0x4E>(x); return x; }
__device__ __forceinline__ float sum8(float x) { x = sum4(x); x += dpp<0x141>(x); return x; }
__device__ __forceinline__ float sum16(float x) { x = sum8(x); x += dpp<0x140>(x); return x; }
__device__ __forceinline__ float wave_sum(float x) { x = sum16(x); x += __shfl_xor(x, 16); x += __shfl_xor(x, 32); return x; }
__device__ __forceinline__ float max8(float x) { x = fmaxf(x, dpp<0xB1>(x)); x = fmaxf(x, dpp<0x4E>(x)); x = fmaxf(x, dpp<0x141>(x)); return x; }
__device__ __forceinline__ float min8(float x) { x = fminf(x, dpp<0xB1>(x)); x = fminf(x, dpp<0x4E>(x)); x = fminf(x, dpp<0x141>(x)); return x; }
__device__ __forceinline__ float wave_scan_incl(float v) {
    v += __builtin_bit_cast(float, __builtin_amdgcn_update_dpp(0, __builtin_bit_cast(int, v), 0x111, 0xf, 0xf, true));
    v += __builtin_bit_cast(float, __builtin_amdgcn_update_dpp(0, __builtin_bit_cast(int, v), 0x112, 0xf, 0xf, true));
    v += __builtin_bit_cast(float, __builtin_amdgcn_update_dpp(0, __builtin_bit_cast(int, v), 0x114, 0xf, 0xf, true));
    v += __builtin_bit_cast(float, __builtin_amdgcn_update_dpp(0, __builtin_bit_cast(int, v), 0x118, 0xf, 0xf, true));
    v += __builtin_bit_cast(float, __builtin_amdgcn_update_dpp(0, __builtin_bit_cast(int, v), 0x142, 0xa, 0xf, false));
    v += __builtin_bit_cast(float, __builtin_amdgcn_update_dpp(0, __builtin_bit_cast(int, v), 0x143, 0xc, 0xf, false));
    return v;
}
__device__ __forceinline__ float sigmoidf_(float x) { return 1.f / (1.f + __expf(-x)); }
__device__ __forceinline__ float siluf_(float x) { return x / (1.f + __expf(-x)); }
__device__ __forceinline__ float softplusf_(float x) { return fmaxf(x, 0.f) + __logf(1.f + __expf(-fabsf(x))); }
__device__ __forceinline__ float gelu_tanh(float x) { const float y = 0.7978845608f * (x + 0.044715f * x * x * x); const float t = 1.f - 2.f / (__expf(2.f * y) + 1.f); return 0.5f * x * (1.f + t); }
__device__ __forceinline__ void unpack8(const v4u r, float (&f)[8]) { f[0] = bflo(r.x); f[1] = bfhi(r.x); f[2] = bflo(r.y); f[3] = bfhi(r.y); f[4] = bflo(r.z); f[5] = bfhi(r.z); f[6] = bflo(r.w); f[7] = bfhi(r.w); }
#define XB_TMO      128
#define XB_XCNT(j)  (256  + 64 * (j))
#define XB_XSUB(j)  (1280 + 64 * (j))
#define XB_XGEN(j)  (2304 + 64 * (j))
#define XB_TOP      3328
#define XB_TOPGEN   3392
#define XCD_BAR_WORDS 3456
#define XB_SPIN_CAP (1u << 18)

__device__ __forceinline__ unsigned xb_ld(unsigned* p)              { return __hip_atomic_load(p, __ATOMIC_RELAXED, __HIP_MEMORY_SCOPE_AGENT); }
__device__ __forceinline__ unsigned xb_add(unsigned* p, unsigned v) { return __hip_atomic_fetch_add(p, v, __ATOMIC_RELAXED, __HIP_MEMORY_SCOPE_AGENT); }
__device__ __forceinline__ unsigned xb_xcc_id() { return (unsigned)__builtin_amdgcn_s_getreg((3 << 11) | 20) & 0xFu; }
#define XB_SPIN(cond, bar) do { unsigned _sp = 0; while (cond) { __builtin_amdgcn_s_sleep(1); \
    if ((++_sp & 255u) == 0u) { if (xb_ld(&(bar)[XB_TMO])) break; if (_sp > XB_SPIN_CAP) { atomicAdd(&(bar)[XB_TMO], 1u); break; } } } } while (0)

struct XcdBarrier {
    unsigned* bar; unsigned x;
    volatile LAS unsigned* st;
};

__device__ __forceinline__ XcdBarrier xcd_barrier_post(unsigned* bar, volatile LAS unsigned* st) {
    XcdBarrier b; b.bar = bar; b.x = xb_xcc_id(); b.st = st;
    if (threadIdx.x == 0) (void)xb_add(&bar[XB_XCNT(b.x)], 1u);
    return b;
}
__device__ __forceinline__ void xcd_barrier_complete(unsigned* bar, unsigned x, unsigned& nloc, unsigned& nx) {
    const unsigned G = gridDim.x * gridDim.y * gridDim.z;
    unsigned sum, cnt, mine, sp = 0u;
    for (;;) {
        sum = 0u; cnt = 0u; mine = 0u;
#pragma unroll
        for (unsigned j = 0; j < 16; ++j) { const unsigned c = xb_ld(&bar[XB_XCNT(j)]); sum += c; cnt += (c > 0u) ? 1u : 0u; mine = (j == x) ? c : mine; }
        if (sum == G) break;
        __builtin_amdgcn_s_sleep(1);
        if ((++sp & 255u) == 0u) { if (xb_ld(&bar[XB_TMO])) break; if (sp > XB_SPIN_CAP) { atomicAdd(&bar[XB_TMO], 1u); break; } }
    }
    nloc = mine > 0u ? mine : 1u; nx = cnt > 0u ? cnt : 1u;
}

__device__ __forceinline__ void xcd_barrier(const XcdBarrier& b) {
    asm volatile("s_waitcnt vmcnt(0)" ::: "memory");
    __syncthreads();
    if (threadIdx.x == 0) {
        unsigned* bar = b.bar;
        __builtin_amdgcn_s_waitcnt(0);
        unsigned nloc = b.st[0], nx = b.st[1];
        if (nloc == 0u) { xcd_barrier_complete(bar, b.x, nloc, nx); b.st[0] = nloc; b.st[1] = nx; }
        const unsigned old = xb_add(&bar[XB_XSUB(b.x)], 1u);
        const unsigned gen = old / nloc;
        if (old + 1u == (gen + 1u) * nloc) {
            __builtin_amdgcn_fence(__ATOMIC_RELEASE, "agent");
            asm volatile("s_waitcnt vmcnt(0)" ::: "memory");
            const unsigned og = xb_add(&bar[XB_TOP], 1u);
            const unsigned tg = og / nx;
            if (og + 1u == (tg + 1u) * nx) xb_add(&bar[XB_TOPGEN], 1u);
            else XB_SPIN(xb_ld(&bar[XB_TOPGEN]) == tg, bar);
            __builtin_amdgcn_fence(__ATOMIC_ACQUIRE, "agent");
            xb_add(&bar[XB_XGEN(b.x)], 1u);
            asm volatile("s_waitcnt vmcnt(0)" ::: "memory");
        } else {
            XB_SPIN(xb_ld(&bar[XB_XGEN(b.x)]) == gen, bar);
            __builtin_amdgcn_fence(__ATOMIC_ACQUIRE, "agent");
            asm volatile("s_waitcnt vmcnt(0)" ::: "memory");
        }
    }
    __syncthreads();
}

struct Params { const float* in[27]; float* out; unsigned char* ws; int ph_lo, ph_hi; };
enum { I_X = 0, I_WIN, I_GMNG, I_GMNB, I_GMWS, I_GMBS, I_CONVW, I_ALOG, I_DTB, I_GDNNG, I_MLIB, I_MLFB, I_MLNG, I_WBR, I_WOUT, I_LN1G, I_LN1B,
       I_WR, I_RB, I_WG, I_WU, I_WD, I_SG, I_SU, I_SD, I_LN2G, I_LN2B };

using pg8::f32x4; using pg8::u32x4; using pg8::Unit; using pg8::HALF; using pg8::BM;

struct EpiMergeH {
    static constexpr bool PERM = true, AFTER_DRAIN = false; static constexpr int MID = MERGE_FP8 ? BW / (2 * pg8::BK) : BW / pg8::BK;
    const bf16* Z; bf16* msum;
    __device__ __forceinline__ void mid(f32x4 (&acc)[2][2][4][2], const Unit& u, int j, int wr, int wc, int fr, int fq) const {
        int row0 = u.pm * BM + wr * 64 + fr; const int col0 = u.pn * BM + wc * 32 + 8 * fq; asm volatile("" : "+v"(row0));
        const bf16* zp = Z + ZC_GATE + (size_t)(j - 1) * D + col0;
#pragma unroll
        for (int am = 0; am < 4; ++am) { const int ai = am >> 1, m0 = (am & 1) * 2; v4u ga[2][2], gb[2][2];
#pragma unroll
            for (int m = 0; m < 2; ++m)
#pragma unroll
                for (int bj = 0; bj < 2; ++bj) { const bf16* q = zp + (size_t)(row0 + ai * HALF + (m0 + m) * 16) * ZC + bj * HALF; ga[m][bj] = *(const v4u*)q; gb[m][bj] = *(const v4u*)(q + D); }
#pragma unroll
            for (int m = 0; m < 2; ++m)
#pragma unroll
                for (int bj = 0; bj < 2; ++bj) { float a[8], b[8]; unpack8(ga[m][bj], a); unpack8(gb[m][bj], b);
#pragma unroll
                    for (int i = 0; i < 8; ++i) { const float ea = __builtin_amdgcn_exp2f(fmaxf(a[i], -60.f) * -1.44269504f), eb = __builtin_amdgcn_exp2f(fmaxf(b[i], -60.f) * -1.44269504f);
                        acc[ai][bj][m0 + m][i >> 2][i & 3] *= (1.f + eb) * __builtin_amdgcn_rcpf(1.f + ea); } }
            asm volatile("" ::: "memory"); }
    }
    __device__ __forceinline__ void operator()(const f32x4 (&acc)[2][2][4][2], const Unit& u, int wr, int wc, int fr, int fq) const {
        const int row0 = u.pm * BM + wr * 64 + fr, col0 = u.pn * BM + wc * 32 + 8 * fq;
#pragma unroll
        for (int ai = 0; ai < 2; ++ai) { v4u gg[4][2];
#pragma unroll
            for (int m = 0; m < 4; ++m)
#pragma unroll
                for (int bj = 0; bj < 2; ++bj) gg[m][bj] = *(const v4u*)(Z + (size_t)(row0 + ai * HALF + m * 16) * ZC + ZC_GATE + 3 * D + col0 + bj * HALF);
#pragma unroll
            for (int m = 0; m < 4; ++m)
#pragma unroll
                for (int bj = 0; bj < 2; ++bj) { const size_t row = (size_t)(row0 + ai * HALF + m * 16); const int col = col0 + bj * HALF; float gl[8]; unpack8(gg[m][bj], gl);
                    f32x4 v0 = acc[ai][bj][m][0], v1 = acc[ai][bj][m][1];
#pragma unroll
                    for (int j = 0; j < 4; ++j) { v0[j] *= sigmoidf_(gl[j]) * MGSC; v1[j] *= sigmoidf_(gl[4 + j]) * MGSC; }
                    unsigned w0 = 0, w1 = 0; w0 = __builtin_amdgcn_cvt_pk_fp8_f32(v0[0], v0[1], w0, false); w0 = __builtin_amdgcn_cvt_pk_fp8_f32(v0[2], v0[3], w0, true); w1 = __builtin_amdgcn_cvt_pk_fp8_f32(v1[0], v1[1], w1, false); w1 = __builtin_amdgcn_cvt_pk_fp8_f32(v1[2], v1[3], w1, true);
                    *(v2u*)((unsigned char*)msum + row * D + col) = (v2u){w0, w1}; }
            asm volatile("" ::: "memory"); }
    }
};
struct EpiResid {
    static constexpr bool PERM = true, AFTER_DRAIN = false; static constexpr int MID = 0;
    const void* X; bf16* Y; float sc; bool xbf;
    __device__ __forceinline__ void operator()(const f32x4 (&acc)[2][2][4][2], const Unit& u, int wr, int wc, int fr, int fq) const {
        const int row0 = u.pm * BM + wr * 64 + fr, col0 = u.pn * BM + wc * 32 + 8 * fq;
#pragma unroll
        for (int ai = 0; ai < 2; ++ai)
#pragma unroll
            for (int m = 0; m < 4; ++m) { const size_t off = (size_t)(row0 + ai * HALF + m * 16) * D + col0;
#pragma unroll
                for (int bj = 0; bj < 2; ++bj) { const f32x4 x0 = ld4(X, off + bj * HALF, xbf), x1 = ld4(X, off + bj * HALF + 4, xbf);
                    const f32x4 v0 = x0 * ALPHA + acc[ai][bj][m][0] * sc, v1 = x1 * ALPHA + acc[ai][bj][m][1] * sc;
                    u32x4 w; w.x = pk2(v0[0], v0[1]); w.y = pk2(v0[2], v0[3]); w.z = pk2(v1[0], v1[1]); w.w = pk2(v1[2], v1[3]); *(u32x4*)(Y + off + bj * HALF) = w; } }
    }
};
struct MoeTab {
    LAS int* t; LAS unsigned short* tok; LAS float* wt; LAS unsigned char* mte;
    __device__ __forceinline__ MoeTab(LAS unsigned char* lds) : t((LAS int*)(lds + TAB_OFF)), tok((LAS unsigned short*)(lds + TAB_OFF + 1024)), wt((LAS float*)(lds + TAB_OFF + 5120)), mte((LAS unsigned char*)(lds + TAB_OFF + 13312)) {}
};
__device__ __forceinline__ void moe_tables(const MoeTab& M, const unsigned* cnt  , int tid, int lane, int wave) {
    __syncthreads();
    if (wave == 0) { const int c = (int)cnt[64 * lane]; const int tiles = (c + 255) >> 8; const float incl = wave_scan_incl((float)tiles);
        M.t[80 + lane] = c; M.t[lane] = (int)incl - tiles; if (lane == 63) { M.t[64] = (int)incl; M.t[65] = (int)incl + T / 256; M.t[80 + 64] = T; } }
    __syncthreads();
    const int Mt = M.t[65];
    for (int mt = tid; mt < Mt; mt += 512) { int e = 0;
        for (int k = 1; k <= 64; ++k) e = (M.t[k] <= mt) ? k : e;
        M.mte[mt] = (unsigned char)e; }
    __syncthreads();
}
struct UpOrder {
    MoeTab M; int n;
    __device__ __forceinline__ bool next(int i, Unit& u) const { if (i >= n) return false; u.pm = M.t[168 + i]; u.pn = M.t[176 + i]; u.aux = i; return true; }
    __device__ __forceinline__ int row_token(int i, int r) const { return (int)M.tok[i * 256 + r]; }
    __device__ __forceinline__ void a_ready(const Unit&) const {}
    __device__ __forceinline__ void done(const Unit&) const {}
};
__device__ __forceinline__ int up_order_build(const MoeTab& M, const int* LIST, const float* WL, int wg, int G, int tid) {
    const int U = 4 * M.t[65];
    if (tid < 8) { const int L = tid * G + wg; if (L < U) { const int mt = L >> 2, q = L & 3, e = M.mte[mt]; M.t[168 + tid] = mt; M.t[176 + tid] = e * 4 + q; M.t[184 + tid] = e; M.t[192 + tid] = mt - M.t[e]; } }
    int n = 0;
#pragma unroll
    for (int i = 0; i < 8; ++i) n += (i * G + wg < U) ? 1 : 0;
    __syncthreads();
    for (int idx = tid; idx < n * 256; idx += 512) { const int i = idx >> 8, r = idx & 255, e = M.t[184 + i], li = M.t[192 + i] * 256 + r;
        int tk = 0; float w = 0.f;
        if (e < NE) { if (li < M.t[80 + e]) { tk = LIST[e * T + li]; w = WL[e * T + li]; } } else { tk = li; w = 1.f; }
        M.tok[idx] = (unsigned short)tk; M.wt[idx] = w; }
    __syncthreads();
    return n;
}
struct EpiGluSparse {
    static constexpr bool PERM = true, AFTER_DRAIN = false; static constexpr int MID = 0;
    LAS const float* wt; bf16* H;
    __device__ __forceinline__ void operator()(const f32x4 (&acc)[2][2][4][2], const Unit& u, int wr, int wc, int fr, int fq) const {
        const int q = u.pn & 3; const int rl0 = wr * 64 + fr, col0 = q * 128 + wc * 32 + 8 * fq;
#pragma unroll
        for (int ai = 0; ai < 2; ++ai)
#pragma unroll
            for (int m = 0; m < 4; ++m) { const int rl = rl0 + ai * HALF + m * 16; const float c = wt[u.aux * 256 + rl]; float h[8];
#pragma unroll
                for (int n = 0; n < 2; ++n)
#pragma unroll
                    for (int j = 0; j < 4; ++j) h[4 * n + j] = siluf_(acc[ai][0][m][n][j] * UPSC) * (acc[ai][1][m][n][j] * UPSC) * c;
#if MOE_DN_FP8
#pragma unroll
                for (int j = 0; j < 8; ++j) h[j] = __builtin_amdgcn_fmed3f(h[j] * HSC, -448.f, 448.f);
                unsigned w0 = 0, w1 = 0; w0 = __builtin_amdgcn_cvt_pk_fp8_f32(h[0], h[1], w0, false); w0 = __builtin_amdgcn_cvt_pk_fp8_f32(h[2], h[3], w0, true); w1 = __builtin_amdgcn_cvt_pk_fp8_f32(h[4], h[5], w1, false); w1 = __builtin_amdgcn_cvt_pk_fp8_f32(h[6], h[7], w1, true);
                *(v2u*)((unsigned char*)H + ((size_t)u.pm * 256 + rl) * ED + col0) = (v2u){w0, w1}; }
#else
                u32x4 w; w.x = pk2(h[0], h[1]); w.y = pk2(h[2], h[3]); w.z = pk2(h[4], h[5]); w.w = pk2(h[6], h[7]);
                *(u32x4*)(H + ((size_t)u.pm * 256 + rl) * ED + col0) = w; }
#endif
    }
};
struct DownOrder {
    MoeTab M; int G, c, U;
    __device__ __forceinline__ bool next(int i, Unit& u) const { const int L = i * G + c; if (L >= U) return false; const int mt = L >> 3; u.pm = mt; u.pn = (int)M.mte[mt] * 8 + (L & 7); u.aux = 0; return true; }
    __device__ __forceinline__ void a_ready(const Unit&) const {}
    __device__ __forceinline__ void done(const Unit&) const {}
};
struct EpiYexp {
    static constexpr bool PERM = true, AFTER_DRAIN = false; static constexpr int MID = 0;
    bf16* Y;
    __device__ __forceinline__ void operator()(const f32x4 (&acc)[2][2][4][2], const Unit& u, int wr, int wc, int fr, int fq) const {
        const int row0 = u.pm * BM + wr * 64 + fr, col0 = (u.pn & 7) * BM + wc * 32 + 8 * fq;
#pragma unroll
        for (int ai = 0; ai < 2; ++ai)
#pragma unroll
            for (int m = 0; m < 4; ++m) { bf16* rowp = Y + (size_t)(row0 + ai * HALF + m * 16) * D + col0;
#pragma unroll
                for (int bj = 0; bj < 2; ++bj) { const f32x4 v0 = acc[ai][bj][m][0] * DNSC, v1 = acc[ai][bj][m][1] * DNSC;
                    u32x4 w; w.x = pk2(v0[0], v0[1]); w.y = pk2(v0[2], v0[3]); w.z = pk2(v1[0], v1[1]); w.w = pk2(v1[2], v1[3]); *(u32x4*)(rowp + bj * HALF) = w; } }
    }
};

struct TrItem { const float* src; bf16* dst; unsigned sld, dld; int f8; };
__device__ __forceinline__ void tr_load(const TrItem& t, int lane, v4f (&v)[8]) { const int r8 = lane >> 3, c4 = lane & 7;
#pragma unroll
    for (int i = 0; i < 8; ++i) v[i] = *(const v4f*)(t.src + (size_t)(8 * i + r8) * t.sld + 4 * c4); }
__device__ __forceinline__ void tr_store(const TrItem& t, const v4f (&v)[8], LAS float* scr, int lane, bool nostore = false) {
    { const int r8 = lane >> 3, c4 = lane & 7;
#pragma unroll
      for (int i = 0; i < 8; ++i) { LAS float* d = scr + (8 * i + r8) * 33 + 4 * c4; d[0] = v[i].x; d[1] = v[i].y; d[2] = v[i].z; d[3] = v[i].w; } }
    LDS_WAIT(); asm volatile("" ::: "memory");
    if (nostore) return;
    if (t.f8) {
        const int c = lane & 3;
#pragma unroll
        for (int j = 0; j < 2; ++j) { const int n = (lane >> 2) + 16 * j; const LAS float* s = scr + (16 * c) * 33 + n; unsigned w[4];
#pragma unroll
            for (int q = 0; q < 4; ++q) { unsigned x = 0; x = __builtin_amdgcn_cvt_pk_fp8_f32(s[(4 * q) * 33] * 64.f, s[(4 * q + 1) * 33] * 64.f, x, false); x = __builtin_amdgcn_cvt_pk_fp8_f32(s[(4 * q + 2) * 33] * 64.f, s[(4 * q + 3) * 33] * 64.f, x, true); w[q] = x; }
            *(v4u*)((unsigned char*)t.dst + (size_t)n * t.dld + 16 * c) = (v4u){w[0], w[1], w[2], w[3]}; }
    } else {
        const int c = lane & 7;
#pragma unroll
        for (int j = 0; j < 4; ++j) { const int n = (lane >> 3) + 8 * j; const LAS float* s = scr + (8 * c) * 33 + n;
            v4u o; o.x = pk2(s[0 * 33], s[1 * 33]); o.y = pk2(s[2 * 33], s[3 * 33]); o.z = pk2(s[4 * 33], s[5 * 33]); o.w = pk2(s[6 * 33], s[7 * 33]);
            *(v4u*)(t.dst + (size_t)n * t.dld + 8 * c) = o; }
    }
    LDS_WAIT(); asm volatile("" ::: "memory");
}
template <int PART> __device__ __forceinline__ TrItem tr_decode(const Params& p, int l, int it) {
    unsigned char* ws = p.ws;
    constexpr int N_IN = (ZC / 32) * (D / 64), N_BR = 4 * (BW / 64) * (D / 32), N_OUT = (D / 64) * (D / 32), N_UP = NEX * 2 * (D / 64) * (ED / 32);
    int r = it; TrItem t; t.f8 = 0;
    if (PART == 0) {
        const float* w_in = p.in[I_WIN] + (size_t)l * D * INC; const float* w_br = p.in[I_WBR] + (size_t)l * 4 * BW * D; const float* w_out = p.in[I_WOUT] + (size_t)l * D * D;
        bf16* WIN = (bf16*)(ws + WS_WIN); bf16* WBR = (bf16*)(ws + WS_WBR); bf16* WOUT = (bf16*)(ws + WS_WOUT);
        if (r < N_IN) { const int kb = r / (ZC / 32), n0 = (r % (ZC / 32)) * 32, k0 = kb * 64; const int sc = n0 + (n0 >= ZC_GATE ? 16 : (n0 >= ZC_MLQ ? 8 : 0));
            t.src = w_in + (size_t)k0 * INC + sc; t.sld = INC; t.dst = (bf16*)((unsigned char*)WIN + (size_t)n0 * D + k0); t.dld = D; t.f8 = 1; return t; } r -= N_IN;
        if (r < N_BR) { const int g = r / 512, rr = r % 512, k0 = (rr / 64) * 64, n0 = (rr % 64) * 32;
            t.src = w_br + ((size_t)g * BW + k0) * D + n0; t.sld = D;
#if MERGE_FP8
            t.dst = (bf16*)((unsigned char*)WBR + (size_t)n0 * BRW + g * BW + k0); t.dld = BRW; t.f8 = 1; return t; }
#else
            t.dst = WBR + (size_t)n0 * BRW + g * BW + k0; t.dld = BRW; return t; }
#endif
        r -= N_BR;
        { const int k0 = (r / 64) * 64, n0 = (r % 64) * 32; t.src = w_out + (size_t)k0 * D + n0; t.sld = D; t.dst = (bf16*)((unsigned char*)WOUT + (size_t)n0 * D + k0); t.dld = D; t.f8 = 1; return t; }
    } else {
        const float* w_g = p.in[I_WG] + (size_t)l * NE * D * ED; const float* w_u = p.in[I_WU] + (size_t)l * NE * D * ED; const float* w_d = p.in[I_WD] + (size_t)l * NE * ED * D;
        const float* s_g = p.in[I_SG] + (size_t)l * D * ED; const float* s_u = p.in[I_SU] + (size_t)l * D * ED; const float* s_d = p.in[I_SD] + (size_t)l * ED * D;
        bf16* WUP = (bf16*)(ws + WS_WUP); bf16* WDN = (bf16*)(ws + WS_WDN);
        if (r < N_UP) { const int e = r / 1024, rr = r % 1024, mat = rr / 512, r2 = rr % 512, k0 = (r2 / 16) * 64, n0 = (r2 % 16) * 32;
            const float* sb = (e < NE) ? ((mat ? w_u : w_g) + (size_t)e * D * ED) : (mat ? s_u : s_g);
            const int drow = e * 1024 + (n0 / 128) * 256 + mat * 128 + (n0 % 128);
            t.src = sb + (size_t)k0 * ED + n0; t.sld = ED;
#if MOE_UP_FP8
            t.dst = (bf16*)((unsigned char*)WUP + (size_t)drow * D + k0); t.dld = D; t.f8 = 1; return t; }
#else
            t.dst = WUP + (size_t)drow * D + k0; t.dld = D; return t; }
#endif
        r -= N_UP;
        { const int e = r / 512, rr = r % 512, k0 = (rr / 64) * 64, n0 = (rr % 64) * 32;
            const float* sb = (e < NE) ? (w_d + (size_t)e * ED * D) : s_d;
            t.src = sb + (size_t)k0 * D + n0; t.sld = D;
#if MOE_DN_FP8
            t.dst = (bf16*)((unsigned char*)WDN + ((size_t)e * D + n0) * ED + k0); t.dld = ED; t.f8 = 1; return t; }
#else
            t.dst = WDN + ((size_t)e * D + n0) * ED + k0; t.dld = ED; return t; }
#endif
    }
}
template <int PART> __device__ __forceinline__ void phase_convert(const Params& p, int l, LAS unsigned char* lds, int gw, int NGW, int wave, int lane, bool nostore = false, int lo = 0, int hi = 1 << 30) {
    constexpr int N_IN = (ZC / 32) * (D / 64), N_BR = 4 * (BW / 64) * (D / 32), N_OUT = (D / 64) * (D / 32), N_UP = NEX * 2 * (D / 64) * (ED / 32), N_DN = NEX * (ED / 64) * (D / 32);
    constexpr int NITEMS = (PART == 0) ? (N_IN + N_BR + N_OUT) : (N_UP + N_DN);
    LAS float* scr = (LAS float*)(lds + wave * 16384);
    const int NIT = hi < NITEMS ? hi : NITEMS;
    if (lo + gw >= NIT) return;
    TrItem cur = tr_decode<PART>(p, l, lo + gw); v4f va[8], vb[8];
    tr_load(cur, lane, va);
    for (int it = lo + gw; it < NIT; it += 2 * NGW) {
        const int i1 = it + NGW, i2 = it + 2 * NGW; TrItem nx = cur;
        if (i1 < NIT) { nx = tr_decode<PART>(p, l, i1); } tr_load(nx, lane, vb);
        tr_store(cur, va, scr, lane, nostore);
        if (i1 >= NIT) break;
        cur = nx; if (i2 < NIT) { cur = tr_decode<PART>(p, l, i2); } tr_load(cur, lane, va);
        tr_store(nx, vb, scr, lane, nostore);
        if (i2 >= NIT) break;
    }
}
__device__ __forceinline__ void phase_xprep(const Params& p, int l, const void* xin, bool xbf, LAS unsigned char* lds, int gw, int NGW, int tid, int lane) {
    const float* w_in = p.in[I_WIN] + (size_t)l * D * INC;
    constexpr int XP = 2052; LAS float* xt = (LAS float*)lds; LAS float* part = (LAS float*)lds;
    const int wave = tid >> 6, n_l = lane & 15, kq = lane >> 4, wg = gw >> 3, G = NGW >> 3;
    const int colw = n_l < 8 ? 4608 + n_l : 6152 + (n_l - 8);
    float bw[64];
#pragma unroll
    for (int q = 0; q < 64; ++q) bw[q] = w_in[(size_t)(256 * wave + 16 * (q >> 2) + 4 * kq + (q & 3)) * INC + colw];
    unsigned char* XB = p.ws + WS_XB; float* SMALL = (float*)(p.ws + WS_SMALL);
    __syncthreads();
    for (int tg = wg; tg < T / 16; tg += G) {
        {   v4f va[8], vb[8]; const size_t m0 = (size_t)tg * 16 + 2 * wave;
#pragma unroll
            for (int j = 0; j < 8; ++j) { va[j] = ld4(xin, m0 * D + 4 * lane + 256 * j, xbf); vb[j] = ld4(xin, (m0 + 1) * D + 4 * lane + 256 * j, xbf); }
#pragma unroll
            for (int rr = 0; rr < 2; ++rr) { unsigned* xo = (unsigned*)(XB + (m0 + rr) * D) + lane;
#pragma unroll
                for (int j = 0; j < 8; ++j) { const v4f v = rr ? vb[j] : va[j]; unsigned w = 0; w = __builtin_amdgcn_cvt_pk_fp8_f32(v.x, v.y, w, false); w = __builtin_amdgcn_cvt_pk_fp8_f32(v.z, v.w, w, true); xo[64 * j] = w;
                    *(LAS v4f*)(xt + (2 * wave + rr) * XP + 4 * lane + 256 * j) = v; } } }
        __syncthreads();
        {   pg8::f32x4 acc[4];
#pragma unroll
            for (int i = 0; i < 4; ++i) acc[i] = (pg8::f32x4){0.f, 0.f, 0.f, 0.f};
            const LAS float* xa = xt + n_l * XP + 256 * wave + 4 * kq;
#pragma unroll
            for (int s2 = 0; s2 < 16; ++s2) { const v4f a4 = *(const LAS v4f*)(xa + 16 * s2);
                acc[0] = __builtin_amdgcn_mfma_f32_16x16x4f32(a4.x, bw[4 * s2 + 0], acc[0], 0, 0, 0); acc[1] = __builtin_amdgcn_mfma_f32_16x16x4f32(a4.y, bw[4 * s2 + 1], acc[1], 0, 0, 0);
                acc[2] = __builtin_amdgcn_mfma_f32_16x16x4f32(a4.z, bw[4 * s2 + 2], acc[2], 0, 0, 0); acc[3] = __builtin_amdgcn_mfma_f32_16x16x4f32(a4.w, bw[4 * s2 + 3], acc[3], 0, 0, 0); }
            const pg8::f32x4 tot = (acc[0] + acc[1]) + (acc[2] + acc[3]);
            __syncthreads();
#pragma unroll
            for (int j = 0; j < 4; ++j) part[(wave * 16 + 4 * kq + j) * 16 + n_l] = tot[j]; }
        __syncthreads();
        if (tid < 256) { float a = 0.f;
#pragma unroll
            for (int w = 0; w < 8; ++w) a += part[w * 256 + tid];
            SMALL[(size_t)tg * 256 + tid] = a; }
        __syncthreads();
    }
}


typedef short bf16x8_t __attribute__((ext_vector_type(8)));
__device__ __forceinline__ void ml_pre_item(const Params& p, int l, LAS unsigned char* lds, int item, int tid, int wave, int lane) {
    const int h = item & 3, n = item >> 2; const size_t t0 = (size_t)n * 64;
    const bf16* Z = (const bf16*)(p.ws + WS_Z); const float* SMALL = (const float*)(p.ws + WS_SMALL);
    bf16* MQ = (bf16*)(p.ws + WS_MQ) + (size_t)item * 4096; bf16* MS = (bf16*)(p.ws + WS_MS) + (size_t)item * 4096; bf16* MK = (bf16*)(p.ws + WS_MK) + (size_t)item * 4096;
    bf16* MV = (bf16*)(p.ws + WS_MV) + (size_t)item * 9216; float* MFL = (float*)(p.ws + WS_MFL);
    LAS float* qs = (LAS float*)lds;
    LAS float* ks = qs + 64 * 65;
    LAS float* bs = ks + 64 * 65;
    LAS unsigned short* vs = (LAS unsigned short*)(bs + 128);
    { const int tk = tid >> 3, c8 = tid & 7; float f[8];
      unpack8(*(const v4u*)(Z + (t0 + tk) * ZC + ZC_MLQ + h * 64 + 8 * c8), f);
#pragma unroll
      for (int i = 0; i < 8; ++i) qs[tk * 65 + 8 * c8 + i] = f[i];
      unpack8(*(const v4u*)(Z + (t0 + tk) * ZC + ZC_MLK + h * 64 + 8 * c8), f);
#pragma unroll
      for (int i = 0; i < 8; ++i) ks[tk * 65 + 8 * c8 + i] = f[i]; }
#pragma unroll
    for (int r = 0; r < 2; ++r) { const int idx = tid + 512 * r, tk = idx >> 4, c8 = idx & 15;
        *(LAS v4u*)(vs + tk * 136 + 8 * c8) = *(const v4u*)(Z + (t0 + tk) * ZC + ZC_MLV + h * 128 + 8 * c8); }
    if (wave == 0) { const float fp = SMALL[(t0 + lane) * 16 + 12 + h] + p.in[I_MLFB][l * 4 + h]; const float lf = -softplusf_(-fp);
        bs[lane] = wave_scan_incl(lf); bs[64 + lane] = SMALL[(t0 + lane) * 16 + 8 + h] + p.in[I_MLIB][l * 4 + h]; }
    __syncthreads();
    const float blast = bs[63];
    { const int i = tid >> 3, jb = tid & 7; const float bi = bs[i];
      { const float e = __expf(bi) * 0.125f; float o[8];
#pragma unroll
        for (int x = 0; x < 8; ++x) o[x] = qs[i * 65 + 8 * jb + x] * e;
        v4u w; w.x = pk2(o[0], o[1]); w.y = pk2(o[2], o[3]); w.z = pk2(o[4], o[5]); w.w = pk2(o[6], o[7]); *(v4u*)(MQ + i * 64 + 8 * jb) = w; }
      {
          const int ti = wave >> 1, c16 = lane & 15, g4 = lane >> 4, i2 = 16 * ti + c16; const float bi2 = bs[i2];
#define ML_F8(dst, base) do { const LAS float* _b = (base); const v4u _w = (v4u){pg8::cvt_pk_bf16(_b[0], _b[1]), pg8::cvt_pk_bf16(_b[2], _b[3]), pg8::cvt_pk_bf16(_b[4], _b[5]), pg8::cvt_pk_bf16(_b[6], _b[7])}; dst = __builtin_bit_cast(bf16x8_t, _w); } while (0)
          bf16x8_t bq[2];
#pragma unroll
          for (int s2 = 0; s2 < 2; ++s2) ML_F8(bq[s2], qs + i2 * 65 + 32 * s2 + 8 * g4);
#pragma unroll
          for (int jj = 0; jj < 2; ++jj) { const int tj = 2 * (wave & 1) + jj; v2u sw = (v2u){0u, 0u};
              if (tj <= ti) { pg8::f32x4 d = {0.f, 0.f, 0.f, 0.f};
#pragma unroll
                  for (int s2 = 0; s2 < 2; ++s2) { bf16x8_t a; ML_F8(a, ks + (16 * tj + c16) * 65 + 32 * s2 + 8 * g4); d = __builtin_amdgcn_mfma_f32_16x16x32_bf16(a, bq[s2], d, 0, 0, 0); }
                  float v4[4];
#pragma unroll
                  for (int r = 0; r < 4; ++r) { const int j = 16 * tj + 4 * g4 + r; v4[r] = (j <= i2) ? __expf(bi2 - bs[j] + bs[64 + j]) * d[r] * 0.125f : 0.f; }
                  sw = (v2u){pk2(v4[0], v4[1]), pk2(v4[2], v4[3])}; }
              *(v2u*)(MS + i2 * 64 + 16 * tj + 4 * g4) = sw; }
#undef ML_F8
      }
      { float o[8];
#pragma unroll
        for (int x = 0; x < 8; ++x) { const int j = 8 * jb + x; o[x] = ks[j * 65 + i] * __expf(blast - bs[j] + bs[64 + j]); }
        v4u w; w.x = pk2(o[0], o[1]); w.y = pk2(o[2], o[3]); w.z = pk2(o[4], o[5]); w.w = pk2(o[6], o[7]); *(v4u*)(MK + i * 64 + 8 * jb) = w; }
    }
    { const int c = tid >> 2, jq = tid & 3; unsigned w[8];
#pragma unroll
      for (int x = 0; x < 8; ++x) w[x] = (unsigned)vs[(16 * jq + 2 * x) * 136 + c] | ((unsigned)vs[(16 * jq + 2 * x + 1) * 136 + c] << 16);
      *(v4u*)(MV + c * 64 + 16 * jq) = (v4u){w[0], w[1], w[2], w[3]}; *(v4u*)(MV + c * 64 + 16 * jq + 8) = (v4u){w[4], w[5], w[6], w[7]};
      if (tid < 64) { const int c2 = 128 + (tid >> 2); const unsigned one = (c2 == 128) ? 0x3F803F80u : 0u;
          *(v4u*)(MV + c2 * 64 + 16 * jq) = (v4u){one, one, one, one}; *(v4u*)(MV + c2 * 64 + 16 * jq + 8) = (v4u){one, one, one, one}; } }
    if (tid == 0) MFL[item] = __expf(blast);
    __syncthreads();
}
struct MlFrags { bf16x8_t q[2], s[2], kt[2], vt[2]; float fl; };
__device__ __forceinline__ void ml_load(MlFrags& F, const Params& p, int item, int offA, int offV) {
    const bf16* MQ = (const bf16*)(p.ws + WS_MQ) + (size_t)item * 4096; const bf16* MS = (const bf16*)(p.ws + WS_MS) + (size_t)item * 4096; const bf16* MK = (const bf16*)(p.ws + WS_MK) + (size_t)item * 4096;
    const bf16* MV = (const bf16*)(p.ws + WS_MV) + (size_t)item * 9216;
#pragma unroll
    for (int ks = 0; ks < 2; ++ks) { F.q[ks] = *(const bf16x8_t*)(MQ + offA + 32 * ks); F.s[ks] = *(const bf16x8_t*)(MS + offA + 32 * ks); F.kt[ks] = *(const bf16x8_t*)(MK + offA + 32 * ks); F.vt[ks] = *(const bf16x8_t*)(MV + offV + 32 * ks); }
    F.fl = ((const float*)(p.ws + WS_MFL))[item];
}
__device__ __forceinline__ void ml_seq(const Params& p, LAS unsigned char* lds, int wgi, int wave, int lane) {
    const int u = wgi * 2 + (wave >> 2), wi = wave & 3, h = u / 9, sl = u % 9, g = lane >> 4, c = lane & 15;
    LAS unsigned short* CT = (LAS unsigned short*)(lds + (wave >> 2) * 4096);
    float* HO = (float*)(p.ws + WS_HO); float* HDEN = (float*)(p.ws + WS_HDEN);
    const int offA = (16 * wi + c) * 64 + 8 * g, offV = (16 * sl + c) * 64 + 8 * g;
    *(LAS v2u*)(CT + c * 64 + 16 * wi + 4 * g) = (v2u){0u, 0u};
    pg8::f32x4 Cacc = {0.f, 0.f, 0.f, 0.f};
    __syncthreads();
    MlFrags F0, F1;
    ml_load(F0, p, h, offA, offV);
#define ML_STEP(F, n_) do { const int cur = (n_) & 1; \
        const bf16x8_t c0 = *(const LAS bf16x8_t*)(CT + cur * 1024 + c * 64 + 8 * g), c1 = *(const LAS bf16x8_t*)(CT + cur * 1024 + c * 64 + 32 + 8 * g); \
        pg8::f32x4 num = {0.f, 0.f, 0.f, 0.f}; \
        num = __builtin_amdgcn_mfma_f32_16x16x32_bf16(F.q[0], c0, num, 0, 0, 0); num = __builtin_amdgcn_mfma_f32_16x16x32_bf16(F.q[1], c1, num, 0, 0, 0); \
        num = __builtin_amdgcn_mfma_f32_16x16x32_bf16(F.s[0], F.vt[0], num, 0, 0, 0); num = __builtin_amdgcn_mfma_f32_16x16x32_bf16(F.s[1], F.vt[1], num, 0, 0, 0); \
        Cacc = Cacc * F.fl; \
        Cacc = __builtin_amdgcn_mfma_f32_16x16x32_bf16(F.kt[0], F.vt[0], Cacc, 0, 0, 0); Cacc = __builtin_amdgcn_mfma_f32_16x16x32_bf16(F.kt[1], F.vt[1], Cacc, 0, 0, 0); \
        { v2u w; w.x = pk2(Cacc[0], Cacc[1]); w.y = pk2(Cacc[2], Cacc[3]); *(LAS v2u*)(CT + (cur ^ 1) * 1024 + c * 64 + 16 * wi + 4 * g) = w; } \
        { const size_t tb = (size_t)(n_) * 64 + 16 * wi + 4 * g; \
          if (sl < 8) { _Pragma("unroll") for (int r = 0; r < 4; ++r) HO[(tb + r) * BW + h * 128 + 16 * sl + c] = num[r]; } \
          else if (c == 0) { _Pragma("unroll") for (int r = 0; r < 4; ++r) HDEN[(tb + r) * 4 + h] = num[r]; } } \
        LDS_BAR(); } while (0)
    for (int n = 0; n < T / 64; n += 2) {
        ml_load(F1, p, (n + 1) * 4 + h, offA, offV);
        ML_STEP(F0, n);
        ml_load(F0, p, ((n + 2 < T / 64) ? n + 2 : n) * 4 + h, offA, offV);
        ML_STEP(F1, n + 1);
    }
#undef ML_STEP
}


constexpr int QP = 132;
__device__ __forceinline__ void gdn_pre_item(const Params& p, int l, LAS unsigned char* lds, int item, int tid, int wave, int lane) {
    const int h = item & 3, n = item >> 2; const size_t t0 = (size_t)n * 64;
    const bf16* Z = (const bf16*)(p.ws + WS_Z); const float* SMALL = (const float*)(p.ws + WS_SMALL);
    float* GU = (float*)(p.ws + WS_GU) + (size_t)item * 8192; bf16* GNW = (bf16*)(p.ws + WS_GNW) + (size_t)item * 8192; bf16* GQG = (bf16*)(p.ws + WS_GQG) + (size_t)item * 8192;
    bf16* GAT = (bf16*)(p.ws + WS_GAT) + (size_t)item * 4096; bf16* GKT = (bf16*)(p.ws + WS_GKT) + (size_t)item * 8192; float* GDL = (float*)(p.ws + WS_GDL);
    const float* cw = p.in[I_CONVW] + (size_t)l * 4 * 1536;
    LAS float* qs = (LAS float*)lds; LAS float* ks = qs + 64 * QP; LAS float* vs = ks + 64 * QP; LAS float* Ls = vs + 64 * QP;   LAS float* gcs = Ls + 64 * 68; LAS float* bts = gcs + 64; LAS float* btg = bts + 64;
    LAS unsigned short* zq = (LAS unsigned short*)(lds + 131584); LAS unsigned short* zk = (LAS unsigned short*)Ls; LAS unsigned short* zv = (LAS unsigned short*)vs; LAS float* cwl = btg + 64;
    float gate_b = 0.f, gate_a = 0.f; if (wave == 0) { gate_b = SMALL[(t0 + lane) * 16 + h]; gate_a = SMALL[(t0 + lane) * 16 + 4 + h]; }
    {   v4u zr[7]; v4f wr4 = (v4f){0.f, 0.f, 0.f, 0.f};
#pragma unroll
        for (int q = 0; q < 7; ++q) { const int idx = tid + 512 * q; zr[q] = (v4u){0u, 0u, 0u, 0u};
            if (idx < 3216) { const int seg = idx / 1072, rem = idx % 1072, r = rem >> 4, c16 = rem & 15; const long tt = (long)t0 - 3 + r;
                if (tt >= 0) zr[q] = *(const v4u*)(Z + (size_t)tt * ZC + ZC_GDN + seg * 512 + h * 128 + 8 * c16); } }
        if (tid < 384) { const int j = tid / 96, rest = tid % 96, i = rest >> 5, c4 = rest & 31; wr4 = *(const v4f*)(cw + j * 1536 + i * 512 + h * 128 + 4 * c4); }
#pragma unroll
        for (int q = 0; q < 7; ++q) { const int idx = tid + 512 * q;
            if (idx < 3216) { const int seg = idx / 1072, rem = idx % 1072; LAS unsigned short* zb = seg == 0 ? zq : (seg == 1 ? zk : zv); *(LAS v4u*)(zb + 8 * rem) = zr[q]; } }
        if (tid < 384) *(LAS v4f*)(cwl + 4 * tid) = wr4;
    }
    __syncthreads();
    { const int tk = tid >> 3, part = tid & 7; float av[16];
#pragma unroll 1
      for (int i = 0; i < 3; ++i) { float a[16]; const LAS unsigned short* zb = i == 0 ? zq : (i == 1 ? zk : zv);
#pragma unroll
        for (int x = 0; x < 16; ++x) a[x] = 0.f;
#pragma unroll
        for (int j = 0; j < 4; ++j) { const LAS unsigned short* src = zb + (tk + j) * 128 + 16 * part; float x0[8], x1[8]; unpack8(*(const LAS v4u*)src, x0); unpack8(*(const LAS v4u*)(src + 8), x1);
            const LAS float* wp = cwl + (j * 3 + i) * 128 + 16 * part;
#pragma unroll
            for (int x4 = 0; x4 < 2; ++x4) { const v4f w0 = *(const LAS v4f*)(wp + 4 * x4), w1 = *(const LAS v4f*)(wp + 8 + 4 * x4);
                a[4 * x4] += w0.x * x0[4 * x4]; a[4 * x4 + 1] += w0.y * x0[4 * x4 + 1]; a[4 * x4 + 2] += w0.z * x0[4 * x4 + 2]; a[4 * x4 + 3] += w0.w * x0[4 * x4 + 3];
                a[8 + 4 * x4] += w1.x * x1[4 * x4]; a[8 + 4 * x4 + 1] += w1.y * x1[4 * x4 + 1]; a[8 + 4 * x4 + 2] += w1.z * x1[4 * x4 + 2]; a[8 + 4 * x4 + 3] += w1.w * x1[4 * x4 + 3]; } }
        float ss = 0.f;
#pragma unroll
        for (int x = 0; x < 16; ++x) { a[x] = siluf_(a[x]); ss += a[x] * a[x]; }
        if (i < 2) { ss = sum8(ss); const float r = rsqrtf(ss + 1e-6f) * (i == 0 ? 0.08838834764831845f : 1.f);
#pragma unroll
            for (int x = 0; x < 16; ++x) a[x] *= r;
            LAS float* dst = (i == 0 ? qs : ks) + tk * QP + 16 * part;
#pragma unroll
            for (int x4 = 0; x4 < 4; ++x4) *(LAS v4f*)(dst + 4 * x4) = (v4f){a[4 * x4], a[4 * x4 + 1], a[4 * x4 + 2], a[4 * x4 + 3]}; }
        else {
#pragma unroll
            for (int x = 0; x < 16; ++x) av[x] = a[x]; } }
      __syncthreads();
      { LAS float* dst = vs + tk * QP + 16 * part;
#pragma unroll
        for (int x4 = 0; x4 < 4; ++x4) *(LAS v4f*)(dst + 4 * x4) = (v4f){av[4 * x4], av[4 * x4 + 1], av[4 * x4 + 2], av[4 * x4 + 3]}; } }
    if (wave == 0) { const float bb = gate_b, aa = gate_a;
        const float g = -__expf(p.in[I_ALOG][l * 4 + h]) * softplusf_(aa + p.in[I_DTB][l * 4 + h]);
        const float gc = wave_scan_incl(g), bt = sigmoidf_(bb); gcs[lane] = gc; bts[lane] = bt; btg[lane] = bt * __expf(gc); }
    __syncthreads();
    { const int ti = wave >> 1, c16 = lane & 15, g4 = lane >> 4, i = 16 * ti + c16; const float gi = gcs[i], bi = bts[i];
#define GDN_F8(dst, base) do { const v4f _a = *(const LAS v4f*)(base), _b = *(const LAS v4f*)((base) + 4); const v4u _w = (v4u){pg8::cvt_pk_bf16(_a.x, _a.y), pg8::cvt_pk_bf16(_a.z, _a.w), pg8::cvt_pk_bf16(_b.x, _b.y), pg8::cvt_pk_bf16(_b.z, _b.w)}; dst = __builtin_bit_cast(bf16x8_t, _w); } while (0)
      bf16x8_t bk[4], bq[4];
#pragma unroll
      for (int s4 = 0; s4 < 4; ++s4) { GDN_F8(bk[s4], ks + i * QP + 32 * s4 + 8 * g4); GDN_F8(bq[s4], qs + i * QP + 32 * s4 + 8 * g4); }
#pragma unroll
      for (int jj = 0; jj < 2; ++jj) { const int tj = 2 * (wave & 1) + jj; v4f lv = (v4f){0.f, 0.f, 0.f, 0.f}; v2u aw = (v2u){0u, 0u};
          if (tj <= ti) { pg8::f32x4 dk = {0.f, 0.f, 0.f, 0.f}, dq = {0.f, 0.f, 0.f, 0.f};
#pragma unroll
              for (int s4 = 0; s4 < 4; ++s4) { bf16x8_t a; GDN_F8(a, ks + (16 * tj + c16) * QP + 32 * s4 + 8 * g4);
                  dk = __builtin_amdgcn_mfma_f32_16x16x32_bf16(a, bk[s4], dk, 0, 0, 0); dq = __builtin_amdgcn_mfma_f32_16x16x32_bf16(a, bq[s4], dq, 0, 0, 0); }
              float l4[4], a4[4];
#pragma unroll
              for (int r = 0; r < 4; ++r) { const int j = 16 * tj + 4 * g4 + r; const float dc = __expf(gi - gcs[j]); l4[r] = (j < i) ? bi * dk[r] * dc : 0.f; a4[r] = (j <= i) ? dq[r] * dc : 0.f; }
              lv = (v4f){l4[0], l4[1], l4[2], l4[3]}; aw = (v2u){pk2(a4[0], a4[1]), pk2(a4[2], a4[3])}; }
          *(LAS v4f*)(Ls + i * 68 + 16 * tj + 4 * g4) = lv; *(v2u*)(GAT + i * 64 + 16 * tj + 4 * g4) = aw; }
#undef GDN_F8
    }
    __syncthreads();
    if (tid < 256) {
        const int c = tid; int vz; asm volatile("v_mov_b32 %0, 0" : "=v"(vz));
        const LAS float* rp = (c < 128) ? (vs + c) : (ks + (c - 128)); const LAS float* mp = ((c < 128) ? bts : btg) + vz;
#define GDN_RHS(i) (rp[(i) * QP] * mp[(i)])
#define GDN_L4(i, j4) (*(const LAS v4f*)(Ls + (i) * 68 + 4 * (j4) + vz))
        float x0 = GDN_RHS(0); __builtin_amdgcn_sched_barrier(0);
        float x1 = GDN_RHS(1); { const v4f l0 = GDN_L4(1, 0); __builtin_amdgcn_sched_barrier(0); x1 -= l0.x * x0; } __builtin_amdgcn_sched_barrier(0);
        float x2 = GDN_RHS(2); { const v4f l0 = GDN_L4(2, 0); __builtin_amdgcn_sched_barrier(0); x2 -= l0.x * x0; x2 -= l0.y * x1; } __builtin_amdgcn_sched_barrier(0);
        float x3 = GDN_RHS(3); { const v4f l0 = GDN_L4(3, 0); __builtin_amdgcn_sched_barrier(0); x3 -= l0.x * x0; x3 -= l0.y * x1; x3 -= l0.z * x2; } __builtin_amdgcn_sched_barrier(0);
        float x4 = GDN_RHS(4); { const v4f l0 = GDN_L4(4, 0); __builtin_amdgcn_sched_barrier(0); x4 -= l0.x * x0; x4 -= l0.y * x1; x4 -= l0.z * x2; x4 -= l0.w * x3; } __builtin_amdgcn_sched_barrier(0);
        float x5 = GDN_RHS(5); { const v4f l0 = GDN_L4(5, 0); const v4f l1 = GDN_L4(5, 1); __builtin_amdgcn_sched_barrier(0); x5 -= l0.x * x0; x5 -= l0.y * x1; x5 -= l0.z * x2; x5 -= l0.w * x3; x5 -= l1.x * x4; } __builtin_amdgcn_sched_barrier(0);
        float x6 = GDN_RHS(6); { const v4f l0 = GDN_L4(6, 0); const v4f l1 = GDN_L4(6, 1); __builtin_amdgcn_sched_barrier(0); x6 -= l0.x * x0; x6 -= l0.y * x1; x6 -= l0.z * x2; x6 -= l0.w * x3; x6 -= l1.x * x4; x6 -= l1.y * x5; } __builtin_amdgcn_sched_barrier(0);
        float x7 = GDN_RHS(7); { const v4f l0 = GDN_L4(7, 0); const v4f l1 = GDN_L4(7, 1); __builtin_amdgcn_sched_barrier(0); x7 -= l0.x * x0; x7 -= l0.y * x1; x7 -= l0.z * x2; x7 -= l0.w * x3; x7 -= l1.x * x4; x7 -= l1.y * x5; x7 -= l1.z * x6; } __builtin_amdgcn_sched_barrier(0);
        float x8 = GDN_RHS(8); { const v4f l0 = GDN_L4(8, 0); const v4f l1 = GDN_L4(8, 1); __builtin_amdgcn_sched_barrier(0); x8 -= l0.x * x0; x8 -= l0.y * x1; x8 -= l0.z * x2; x8 -= l0.w * x3; x8 -= l1.x * x4; x8 -= l1.y * x5; x8 -= l1.z * x6; x8 -= l1.w * x7; } __builtin_amdgcn_sched_barrier(0);
        float x9 = GDN_RHS(9); { const v4f l0 = GDN_L4(9, 0); const v4f l1 = GDN_L4(9, 1); const v4f l2 = GDN_L4(9, 2); __builtin_amdgcn_sched_barrier(0); x9 -= l0.x * x0; x9 -= l0.y * x1; x9 -= l0.z * x2; x9 -= l0.w * x3; x9 -= l1.x * x4; x9 -= l1.y * x5; x9 -= l1.z * x6; x9 -= l1.w * x7; x9 -= l2.x * x8; } __builtin_amdgcn_sched_barrier(0);
        float x10 = GDN_RHS(10); { const v4f l0 = GDN_L4(10, 0); const v4f l1 = GDN_L4(10, 1); const v4f l2 = GDN_L4(10, 2); __builtin_amdgcn_sched_barrier(0); x10 -= l0.x * x0; x10 -= l0.y * x1; x10 -= l0.z * x2; x10 -= l0.w * x3; x10 -= l1.x * x4; x10 -= l1.y * x5; x10 -= l1.z * x6; x10 -= l1.w * x7; x10 -= l2.x * x8; x10 -= l2.y * x9; } __builtin_amdgcn_sched_barrier(0);
        float x11 = GDN_RHS(11); { const v4f l0 = GDN_L4(11, 0); const v4f l1 = GDN_L4(11, 1); const v4f l2 = GDN_L4(11, 2); __builtin_amdgcn_sched_barrier(0); x11 -= l0.x * x0; x11 -= l0.y * x1; x11 -= l0.z * x2; x11 -= l0.w * x3; x11 -= l1.x * x4; x11 -= l1.y * x5; x11 -= l1.z * x6; x11 -= l1.w * x7; x11 -= l2.x * x8; x11 -= l2.y * x9; x11 -= l2.z * x10; } __builtin_amdgcn_sched_barrier(0);
        float x12 = GDN_RHS(12); { const v4f l0 = GDN_L4(12, 0); const v4f l1 = GDN_L4(12, 1); const v4f l2 = GDN_L4(12, 2); __builtin_amdgcn_sched_barrier(0); x12 -= l0.x * x0; x12 -= l0.y * x1; x12 -= l0.z * x2; x12 -= l0.w * x3; x12 -= l1.x * x4; x12 -= l1.y * x5; x12 -= l1.z * x6; x12 -= l1.w * x7; x12 -= l2.x * x8; x12 -= l2.y * x9; x12 -= l2.z * x10; x12 -= l2.w * x11; } __builtin_amdgcn_sched_barrier(0);
        float x13 = GDN_RHS(13); { const v4f l0 = GDN_L4(13, 0); const v4f l1 = GDN_L4(13, 1); const v4f l2 = GDN_L4(13, 2); const v4f l3 = GDN_L4(13, 3); __builtin_amdgcn_sched_barrier(0); x13 -= l0.x * x0; x13 -= l0.y * x1; x13 -= l0.z * x2; x13 -= l0.w * x3; x13 -= l1.x * x4; x13 -= l1.y * x5; x13 -= l1.z * x6; x13 -= l1.w * x7; x13 -= l2.x * x8; x13 -= l2.y * x9; x13 -= l2.z * x10; x13 -= l2.w * x11; x13 -= l3.x * x12; } __builtin_amdgcn_sched_barrier(0);
        float x14 = GDN_RHS(14); { const v4f l0 = GDN_L4(14, 0); const v4f l1 = GDN_L4(14, 1); const v4f l2 = GDN_L4(14, 2); const v4f l3 = GDN_L4(14, 3); __builtin_amdgcn_sched_barrier(0); x14 -= l0.x * x0; x14 -= l0.y * x1; x14 -= l0.z * x2; x14 -= l0.w * x3; x14 -= l1.x * x4; x14 -= l1.y * x5; x14 -= l1.z * x6; x14 -= l1.w * x7; x14 -= l2.x * x8; x14 -= l2.y * x9; x14 -= l2.z * x10; x14 -= l2.w * x11; x14 -= l3.x * x12; x14 -= l3.y * x13; } __builtin_amdgcn_sched_barrier(0);
        float x15 = GDN_RHS(15); { const v4f l0 = GDN_L4(15, 0); const v4f l1 = GDN_L4(15, 1); const v4f l2 = GDN_L4(15, 2); const v4f l3 = GDN_L4(15, 3); __builtin_amdgcn_sched_barrier(0); x15 -= l0.x * x0; x15 -= l0.y * x1; x15 -= l0.z * x2; x15 -= l0.w * x3; x15 -= l1.x * x4; x15 -= l1.y * x5; x15 -= l1.z * x6; x15 -= l1.w * x7; x15 -= l2.x * x8; x15 -= l2.y * x9; x15 -= l2.z * x10; x15 -= l2.w * x11; x15 -= l3.x * x12; x15 -= l3.y * x13; x15 -= l3.z * x14; } __builtin_amdgcn_sched_barrier(0);
        float x16 = GDN_RHS(16); { const v4f l0 = GDN_L4(16, 0); const v4f l1 = GDN_L4(16, 1); const v4f l2 = GDN_L4(16, 2); const v4f l3 = GDN_L4(16, 3); __builtin_amdgcn_sched_barrier(0); x16 -= l0.x * x0; x16 -= l0.y * x1; x16 -= l0.z * x2; x16 -= l0.w * x3; x16 -= l1.x * x4; x16 -= l1.y * x5; x16 -= l1.z * x6; x16 -= l1.w * x7; x16 -= l2.x * x8; x16 -= l2.y * x9; x16 -= l2.z * x10; x16 -= l2.w * x11; x16 -= l3.x * x12; x16 -= l3.y * x13; x16 -= l3.z * x14; x16 -= l3.w * x15; } __builtin_amdgcn_sched_barrier(0);
        float x17 = GDN_RHS(17); { const v4f l0 = GDN_L4(17, 0); const v4f l1 = GDN_L4(17, 1); const v4f l2 = GDN_L4(17, 2); const v4f l3 = GDN_L4(17, 3); const v4f l4 = GDN_L4(17, 4); __builtin_amdgcn_sched_barrier(0); x17 -= l0.x * x0; x17 -= l0.y * x1; x17 -= l0.z * x2; x17 -= l0.w * x3; x17 -= l1.x * x4; x17 -= l1.y * x5; x17 -= l1.z * x6; x17 -= l1.w * x7; x17 -= l2.x * x8; x17 -= l2.y * x9; x17 -= l2.z * x10; x17 -= l2.w * x11; x17 -= l3.x * x12; x17 -= l3.y * x13; x17 -= l3.z * x14; x17 -= l3.w * x15; x17 -= l4.x * x16; } __builtin_amdgcn_sched_barrier(0);
        float x18 = GDN_RHS(18); { const v4f l0 = GDN_L4(18, 0); const v4f l1 = GDN_L4(18, 1); const v4f l2 = GDN_L4(18, 2); const v4f l3 = GDN_L4(18, 3); const v4f l4 = GDN_L4(18, 4); __builtin_amdgcn_sched_barrier(0); x18 -= l0.x * x0; x18 -= l0.y * x1; x18 -= l0.z * x2; x18 -= l0.w * x3; x18 -= l1.x * x4; x18 -= l1.y * x5; x18 -= l1.z * x6; x18 -= l1.w * x7; x18 -= l2.x * x8; x18 -= l2.y * x9; x18 -= l2.z * x10; x18 -= l2.w * x11; x18 -= l3.x * x12; x18 -= l3.y * x13; x18 -= l3.z * x14; x18 -= l3.w * x15; x18 -= l4.x * x16; x18 -= l4.y * x17; } __builtin_amdgcn_sched_barrier(0);
        float x19 = GDN_RHS(19); { const v4f l0 = GDN_L4(19, 0); const v4f l1 = GDN_L4(19, 1); const v4f l2 = GDN_L4(19, 2); const v4f l3 = GDN_L4(19, 3); const v4f l4 = GDN_L4(19, 4); __builtin_amdgcn_sched_barrier(0); x19 -= l0.x * x0; x19 -= l0.y * x1; x19 -= l0.z * x2; x19 -= l0.w * x3; x19 -= l1.x * x4; x19 -= l1.y * x5; x19 -= l1.z * x6; x19 -= l1.w * x7; x19 -= l2.x * x8; x19 -= l2.y * x9; x19 -= l2.z * x10; x19 -= l2.w * x11; x19 -= l3.x * x12; x19 -= l3.y * x13; x19 -= l3.z * x14; x19 -= l3.w * x15; x19 -= l4.x * x16; x19 -= l4.y * x17; x19 -= l4.z * x18; } __builtin_amdgcn_sched_barrier(0);
        float x20 = GDN_RHS(20); { const v4f l0 = GDN_L4(20, 0); const v4f l1 = GDN_L4(20, 1); const v4f l2 = GDN_L4(20, 2); const v4f l3 = GDN_L4(20, 3); const v4f l4 = GDN_L4(20, 4); __builtin_amdgcn_sched_barrier(0); x20 -= l0.x * x0; x20 -= l0.y * x1; x20 -= l0.z * x2; x20 -= l0.w * x3; x20 -= l1.x * x4; x20 -= l1.y * x5; x20 -= l1.z * x6; x20 -= l1.w * x7; x20 -= l2.x * x8; x20 -= l2.y * x9; x20 -= l2.z * x10; x20 -= l2.w * x11; x20 -= l3.x * x12; x20 -= l3.y * x13; x20 -= l3.z * x14; x20 -= l3.w * x15; x20 -= l4.x * x16; x20 -= l4.y * x17; x20 -= l4.z * x18; x20 -= l4.w * x19; } __builtin_amdgcn_sched_barrier(0);
        float x21 = GDN_RHS(21); { const v4f l0 = GDN_L4(21, 0); const v4f l1 = GDN_L4(21, 1); const v4f l2 = GDN_L4(21, 2); const v4f l3 = GDN_L4(21, 3); const v4f l4 = GDN_L4(21, 4); const v4f l5 = GDN_L4(21, 5); __builtin_amdgcn_sched_barrier(0); x21 -= l0.x * x0; x21 -= l0.y * x1; x21 -= l0.z * x2; x21 -= l0.w * x3; x21 -= l1.x * x4; x21 -= l1.y * x5; x21 -= l1.z * x6; x21 -= l1.w * x7; x21 -= l2.x * x8; x21 -= l2.y * x9; x21 -= l2.z * x10; x21 -= l2.w * x11; x21 -= l3.x * x12; x21 -= l3.y * x13; x21 -= l3.z * x14; x21 -= l3.w * x15; x21 -= l4.x * x16; x21 -= l4.y * x17; x21 -= l4.z * x18; x21 -= l4.w * x19; x21 -= l5.x * x20; } __builtin_amdgcn_sched_barrier(0);
        float x22 = GDN_RHS(22); { const v4f l0 = GDN_L4(22, 0); const v4f l1 = GDN_L4(22, 1); const v4f l2 = GDN_L4(22, 2); const v4f l3 = GDN_L4(22, 3); const v4f l4 = GDN_L4(22, 4); const v4f l5 = GDN_L4(22, 5); __builtin_amdgcn_sched_barrier(0); x22 -= l0.x * x0; x22 -= l0.y * x1; x22 -= l0.z * x2; x22 -= l0.w * x3; x22 -= l1.x * x4; x22 -= l1.y * x5; x22 -= l1.z * x6; x22 -= l1.w * x7; x22 -= l2.x * x8; x22 -= l2.y * x9; x22 -= l2.z * x10; x22 -= l2.w * x11; x22 -= l3.x * x12; x22 -= l3.y * x13; x22 -= l3.z * x14; x22 -= l3.w * x15; x22 -= l4.x * x16; x22 -= l4.y * x17; x22 -= l4.z * x18; x22 -= l4.w * x19; x22 -= l5.x * x20; x22 -= l5.y * x21; } __builtin_amdgcn_sched_barrier(0);
        float x23 = GDN_RHS(23); { const v4f l0 = GDN_L4(23, 0); const v4f l1 = GDN_L4(23, 1); const v4f l2 = GDN_L4(23, 2); const v4f l3 = GDN_L4(23, 3); const v4f l4 = GDN_L4(23, 4); const v4f l5 = GDN_L4(23, 5); __builtin_amdgcn_sched_barrier(0); x23 -= l0.x * x0; x23 -= l0.y * x1; x23 -= l0.z * x2; x23 -= l0.w * x3; x23 -= l1.x * x4; x23 -= l1.y * x5; x23 -= l1.z * x6; x23 -= l1.w * x7; x23 -= l2.x * x8; x23 -= l2.y * x9; x23 -= l2.z * x10; x23 -= l2.w * x11; x23 -= l3.x * x12; x23 -= l3.y * x13; x23 -= l3.z * x14; x23 -= l3.w * x15; x23 -= l4.x * x16; x23 -= l4.y * x17; x23 -= l4.z * x18; x23 -= l4.w * x19; x23 -= l5.x * x20; x23 -= l5.y * x21; x23 -= l5.z * x22; } __builtin_amdgcn_sched_barrier(0);
        float x24 = GDN_RHS(24); { const v4f l0 = GDN_L4(24, 0); const v4f l1 = GDN_L4(24, 1); const v4f l2 = GDN_L4(24, 2); const v4f l3 = GDN_L4(24, 3); const v4f l4 = GDN_L4(24, 4); const v4f l5 = GDN_L4(24, 5); __builtin_amdgcn_sched_barrier(0); x24 -= l0.x * x0; x24 -= l0.y * x1; x24 -= l0.z * x2; x24 -= l0.w * x3; x24 -= l1.x * x4; x24 -= l1.y * x5; x24 -= l1.z * x6; x24 -= l1.w * x7; x24 -= l2.x * x8; x24 -= l2.y * x9; x24 -= l2.z * x10; x24 -= l2.w * x11; x24 -= l3.x * x12; x24 -= l3.y * x13; x24 -= l3.z * x14; x24 -= l3.w * x15; x24 -= l4.x * x16; x24 -= l4.y * x17; x24 -= l4.z * x18; x24 -= l4.w * x19; x24 -= l5.x * x20; x24 -= l5.y * x21; x24 -= l5.z * x22; x24 -= l5.w * x23; } __builtin_amdgcn_sched_barrier(0);
        float x25 = GDN_RHS(25); { const v4f l0 = GDN_L4(25, 0); const v4f l1 = GDN_L4(25, 1); const v4f l2 = GDN_L4(25, 2); const v4f l3 = GDN_L4(25, 3); const v4f l4 = GDN_L4(25, 4); const v4f l5 = GDN_L4(25, 5); const v4f l6 = GDN_L4(25, 6); __builtin_amdgcn_sched_barrier(0); x25 -= l0.x * x0; x25 -= l0.y * x1; x25 -= l0.z * x2; x25 -= l0.w * x3; x25 -= l1.x * x4; x25 -= l1.y * x5; x25 -= l1.z * x6; x25 -= l1.w * x7; x25 -= l2.x * x8; x25 -= l2.y * x9; x25 -= l2.z * x10; x25 -= l2.w * x11; x25 -= l3.x * x12; x25 -= l3.y * x13; x25 -= l3.z * x14; x25 -= l3.w * x15; x25 -= l4.x * x16; x25 -= l4.y * x17; x25 -= l4.z * x18; x25 -= l4.w * x19; x25 -= l5.x * x20; x25 -= l5.y * x21; x25 -= l5.z * x22; x25 -= l5.w * x23; x25 -= l6.x * x24; } __builtin_amdgcn_sched_barrier(0);
        float x26 = GDN_RHS(26); { const v4f l0 = GDN_L4(26, 0); const v4f l1 = GDN_L4(26, 1); const v4f l2 = GDN_L4(26, 2); const v4f l3 = GDN_L4(26, 3); const v4f l4 = GDN_L4(26, 4); const v4f l5 = GDN_L4(26, 5); const v4f l6 = GDN_L4(26, 6); __builtin_amdgcn_sched_barrier(0); x26 -= l0.x * x0; x26 -= l0.y * x1; x26 -= l0.z * x2; x26 -= l0.w * x3; x26 -= l1.x * x4; x26 -= l1.y * x5; x26 -= l1.z * x6; x26 -= l1.w * x7; x26 -= l2.x * x8; x26 -= l2.y * x9; x26 -= l2.z * x10; x26 -= l2.w * x11; x26 -= l3.x * x12; x26 -= l3.y * x13; x26 -= l3.z * x14; x26 -= l3.w * x15; x26 -= l4.x * x16; x26 -= l4.y * x17; x26 -= l4.z * x18; x26 -= l4.w * x19; x26 -= l5.x * x20; x26 -= l5.y * x21; x26 -= l5.z * x22; x26 -= l5.w * x23; x26 -= l6.x * x24; x26 -= l6.y * x25; } __builtin_amdgcn_sched_barrier(0);
        float x27 = GDN_RHS(27); { const v4f l0 = GDN_L4(27, 0); const v4f l1 = GDN_L4(27, 1); const v4f l2 = GDN_L4(27, 2); const v4f l3 = GDN_L4(27, 3); const v4f l4 = GDN_L4(27, 4); const v4f l5 = GDN_L4(27, 5); const v4f l6 = GDN_L4(27, 6); __builtin_amdgcn_sched_barrier(0); x27 -= l0.x * x0; x27 -= l0.y * x1; x27 -= l0.z * x2; x27 -= l0.w * x3; x27 -= l1.x * x4; x27 -= l1.y * x5; x27 -= l1.z * x6; x27 -= l1.w * x7; x27 -= l2.x * x8; x27 -= l2.y * x9; x27 -= l2.z * x10; x27 -= l2.w * x11; x27 -= l3.x * x12; x27 -= l3.y * x13; x27 -= l3.z * x14; x27 -= l3.w * x15; x27 -= l4.x * x16; x27 -= l4.y * x17; x27 -= l4.z * x18; x27 -= l4.w * x19; x27 -= l5.x * x20; x27 -= l5.y * x21; x27 -= l5.z * x22; x27 -= l5.w * x23; x27 -= l6.x * x24; x27 -= l6.y * x25; x27 -= l6.z * x26; } __builtin_amdgcn_sched_barrier(0);
        float x28 = GDN_RHS(28); { const v4f l0 = GDN_L4(28, 0); const v4f l1 = GDN_L4(28, 1); const v4f l2 = GDN_L4(28, 2); const v4f l3 = GDN_L4(28, 3); const v4f l4 = GDN_L4(28, 4); const v4f l5 = GDN_L4(28, 5); const v4f l6 = GDN_L4(28, 6); __builtin_amdgcn_sched_barrier(0); x28 -= l0.x * x0; x28 -= l0.y * x1; x28 -= l0.z * x2; x28 -= l0.w * x3; x28 -= l1.x * x4; x28 -= l1.y * x5; x28 -= l1.z * x6; x28 -= l1.w * x7; x28 -= l2.x * x8; x28 -= l2.y * x9; x28 -= l2.z * x10; x28 -= l2.w * x11; x28 -= l3.x * x12; x28 -= l3.y * x13; x28 -= l3.z * x14; x28 -= l3.w * x15; x28 -= l4.x * x16; x28 -= l4.y * x17; x28 -= l4.z * x18; x28 -= l4.w * x19; x28 -= l5.x * x20; x28 -= l5.y * x21; x28 -= l5.z * x22; x28 -= l5.w * x23; x28 -= l6.x * x24; x28 -= l6.y * x25; x28 -= l6.z * x26; x28 -= l6.w * x27; } __builtin_amdgcn_sched_barrier(0);
        float x29 = GDN_RHS(29); { const v4f l0 = GDN_L4(29, 0); const v4f l1 = GDN_L4(29, 1); const v4f l2 = GDN_L4(29, 2); const v4f l3 = GDN_L4(29, 3); const v4f l4 = GDN_L4(29, 4); const v4f l5 = GDN_L4(29, 5); const v4f l6 = GDN_L4(29, 6); const v4f l7 = GDN_L4(29, 7); __builtin_amdgcn_sched_barrier(0); x29 -= l0.x * x0; x29 -= l0.y * x1; x29 -= l0.z * x2; x29 -= l0.w * x3; x29 -= l1.x * x4; x29 -= l1.y * x5; x29 -= l1.z * x6; x29 -= l1.w * x7; x29 -= l2.x * x8; x29 -= l2.y * x9; x29 -= l2.z * x10; x29 -= l2.w * x11; x29 -= l3.x * x12; x29 -= l3.y * x13; x29 -= l3.z * x14; x29 -= l3.w * x15; x29 -= l4.x * x16; x29 -= l4.y * x17; x29 -= l4.z * x18; x29 -= l4.w * x19; x29 -= l5.x * x20; x29 -= l5.y * x21; x29 -= l5.z * x22; x29 -= l5.w * x23; x29 -= l6.x * x24; x29 -= l6.y * x25; x29 -= l6.z * x26; x29 -= l6.w * x27; x29 -= l7.x * x28; } __builtin_amdgcn_sched_barrier(0);
        float x30 = GDN_RHS(30); { const v4f l0 = GDN_L4(30, 0); const v4f l1 = GDN_L4(30, 1); const v4f l2 = GDN_L4(30, 2); const v4f l3 = GDN_L4(30, 3); const v4f l4 = GDN_L4(30, 4); const v4f l5 = GDN_L4(30, 5); const v4f l6 = GDN_L4(30, 6); const v4f l7 = GDN_L4(30, 7); __builtin_amdgcn_sched_barrier(0); x30 -= l0.x * x0; x30 -= l0.y * x1; x30 -= l0.z * x2; x30 -= l0.w * x3; x30 -= l1.x * x4; x30 -= l1.y * x5; x30 -= l1.z * x6; x30 -= l1.w * x7; x30 -= l2.x * x8; x30 -= l2.y * x9; x30 -= l2.z * x10; x30 -= l2.w * x11; x30 -= l3.x * x12; x30 -= l3.y * x13; x30 -= l3.z * x14; x30 -= l3.w * x15; x30 -= l4.x * x16; x30 -= l4.y * x17; x30 -= l4.z * x18; x30 -= l4.w * x19; x30 -= l5.x * x20; x30 -= l5.y * x21; x30 -= l5.z * x22; x30 -= l5.w * x23; x30 -= l6.x * x24; x30 -= l6.y * x25; x30 -= l6.z * x26; x30 -= l6.w * x27; x30 -= l7.x * x28; x30 -= l7.y * x29; } __builtin_amdgcn_sched_barrier(0);
        float x31 = GDN_RHS(31); { const v4f l0 = GDN_L4(31, 0); const v4f l1 = GDN_L4(31, 1); const v4f l2 = GDN_L4(31, 2); const v4f l3 = GDN_L4(31, 3); const v4f l4 = GDN_L4(31, 4); const v4f l5 = GDN_L4(31, 5); const v4f l6 = GDN_L4(31, 6); const v4f l7 = GDN_L4(31, 7); __builtin_amdgcn_sched_barrier(0); x31 -= l0.x * x0; x31 -= l0.y * x1; x31 -= l0.z * x2; x31 -= l0.w * x3; x31 -= l1.x * x4; x31 -= l1.y * x5; x31 -= l1.z * x6; x31 -= l1.w * x7; x31 -= l2.x * x8; x31 -= l2.y * x9; x31 -= l2.z * x10; x31 -= l2.w * x11; x31 -= l3.x * x12; x31 -= l3.y * x13; x31 -= l3.z * x14; x31 -= l3.w * x15; x31 -= l4.x * x16; x31 -= l4.y * x17; x31 -= l4.z * x18; x31 -= l4.w * x19; x31 -= l5.x * x20; x31 -= l5.y * x21; x31 -= l5.z * x22; x31 -= l5.w * x23; x31 -= l6.x * x24; x31 -= l6.y * x25; x31 -= l6.z * x26; x31 -= l6.w * x27; x31 -= l7.x * x28; x31 -= l7.y * x29; x31 -= l7.z * x30; } __builtin_amdgcn_sched_barrier(0);
        float x32 = GDN_RHS(32); { const v4f l0 = GDN_L4(32, 0); const v4f l1 = GDN_L4(32, 1); const v4f l2 = GDN_L4(32, 2); const v4f l3 = GDN_L4(32, 3); const v4f l4 = GDN_L4(32, 4); const v4f l5 = GDN_L4(32, 5); const v4f l6 = GDN_L4(32, 6); const v4f l7 = GDN_L4(32, 7); __builtin_amdgcn_sched_barrier(0); x32 -= l0.x * x0; x32 -= l0.y * x1; x32 -= l0.z * x2; x32 -= l0.w * x3; x32 -= l1.x * x4; x32 -= l1.y * x5; x32 -= l1.z * x6; x32 -= l1.w * x7; x32 -= l2.x * x8; x32 -= l2.y * x9; x32 -= l2.z * x10; x32 -= l2.w * x11; x32 -= l3.x * x12; x32 -= l3.y * x13; x32 -= l3.z * x14; x32 -= l3.w * x15; x32 -= l4.x * x16; x32 -= l4.y * x17; x32 -= l4.z * x18; x32 -= l4.w * x19; x32 -= l5.x * x20; x32 -= l5.y * x21; x32 -= l5.z * x22; x32 -= l5.w * x23; x32 -= l6.x * x24; x32 -= l6.y * x25; x32 -= l6.z * x26; x32 -= l6.w * x27; x32 -= l7.x * x28; x32 -= l7.y * x29; x32 -= l7.z * x30; x32 -= l7.w * x31; } __builtin_amdgcn_sched_barrier(0);
        float x33 = GDN_RHS(33); { const v4f l0 = GDN_L4(33, 0); const v4f l1 = GDN_L4(33, 1); const v4f l2 = GDN_L4(33, 2); const v4f l3 = GDN_L4(33, 3); const v4f l4 = GDN_L4(33, 4); const v4f l5 = GDN_L4(33, 5); const v4f l6 = GDN_L4(33, 6); const v4f l7 = GDN_L4(33, 7); __builtin_amdgcn_sched_barrier(0); x33 -= l0.x * x0; x33 -= l0.y * x1; x33 -= l0.z * x2; x33 -= l0.w * x3; x33 -= l1.x * x4; x33 -= l1.y * x5; x33 -= l1.z * x6; x33 -= l1.w * x7; x33 -= l2.x * x8; x33 -= l2.y * x9; x33 -= l2.z * x10; x33 -= l2.w * x11; x33 -= l3.x * x12; x33 -= l3.y * x13; x33 -= l3.z * x14; x33 -= l3.w * x15; x33 -= l4.x * x16; x33 -= l4.y * x17; x33 -= l4.z * x18; x33 -= l4.w * x19; x33 -= l5.x * x20; x33 -= l5.y * x21; x33 -= l5.z * x22; x33 -= l5.w * x23; x33 -= l6.x * x24; x33 -= l6.y * x25; x33 -= l6.z * x26; x33 -= l6.w * x27; x33 -= l7.x * x28; x33 -= l7.y * x29; x33 -= l7.z * x30; x33 -= l7.w * x31; } __builtin_amdgcn_sched_barrier(0); { const v4f l8 = GDN_L4(33, 8); __builtin_amdgcn_sched_barrier(0); x33 -= l8.x * x32; } __builtin_amdgcn_sched_barrier(0);
        float x34 = GDN_RHS(34); { const v4f l0 = GDN_L4(34, 0); const v4f l1 = GDN_L4(34, 1); const v4f l2 = GDN_L4(34, 2); const v4f l3 = GDN_L4(34, 3); const v4f l4 = GDN_L4(34, 4); const v4f l5 = GDN_L4(34, 5); const v4f l6 = GDN_L4(34, 6); const v4f l7 = GDN_L4(34, 7); __builtin_amdgcn_sched_barrier(0); x34 -= l0.x * x0; x34 -= l0.y * x1; x34 -= l0.z * x2; x34 -= l0.w * x3; x34 -= l1.x * x4; x34 -= l1.y * x5; x34 -= l1.z * x6; x34 -= l1.w * x7; x34 -= l2.x * x8; x34 -= l2.y * x9; x34 -= l2.z * x10; x34 -= l2.w * x11; x34 -= l3.x * x12; x34 -= l3.y * x13; x34 -= l3.z * x14; x34 -= l3.w * x15; x34 -= l4.x * x16; x34 -= l4.y * x17; x34 -= l4.z * x18; x34 -= l4.w * x19; x34 -= l5.x * x20; x34 -= l5.y * x21; x34 -= l5.z * x22; x34 -= l5.w * x23; x34 -= l6.x * x24; x34 -= l6.y * x25; x34 -= l6.z * x26; x34 -= l6.w * x27; x34 -= l7.x * x28; x34 -= l7.y * x29; x34 -= l7.z * x30; x34 -= l7.w * x31; } __builtin_amdgcn_sched_barrier(0); { const v4f l8 = GDN_L4(34, 8); __builtin_amdgcn_sched_barrier(0); x34 -= l8.x * x32; x34 -= l8.y * x33; } __builtin_amdgcn_sched_barrier(0);
        float x35 = GDN_RHS(35); { const v4f l0 = GDN_L4(35, 0); const v4f l1 = GDN_L4(35, 1); const v4f l2 = GDN_L4(35, 2); const v4f l3 = GDN_L4(35, 3); const v4f l4 = GDN_L4(35, 4); const v4f l5 = GDN_L4(35, 5); const v4f l6 = GDN_L4(35, 6); const v4f l7 = GDN_L4(35, 7); __builtin_amdgcn_sched_barrier(0); x35 -= l0.x * x0; x35 -= l0.y * x1; x35 -= l0.z * x2; x35 -= l0.w * x3; x35 -= l1.x * x4; x35 -= l1.y * x5; x35 -= l1.z * x6; x35 -= l1.w * x7; x35 -= l2.x * x8; x35 -= l2.y * x9; x35 -= l2.z * x10; x35 -= l2.w * x11; x35 -= l3.x * x12; x35 -= l3.y * x13; x35 -= l3.z * x14; x35 -= l3.w * x15; x35 -= l4.x * x16; x35 -= l4.y * x17; x35 -= l4.z * x18; x35 -= l4.w * x19; x35 -= l5.x * x20; x35 -= l5.y * x21; x35 -= l5.z * x22; x35 -= l5.w * x23; x35 -= l6.x * x24; x35 -= l6.y * x25; x35 -= l6.z * x26; x35 -= l6.w * x27; x35 -= l7.x * x28; x35 -= l7.y * x29; x35 -= l7.z * x30; x35 -= l7.w * x31; } __builtin_amdgcn_sched_barrier(0); { const v4f l8 = GDN_L4(35, 8); __builtin_amdgcn_sched_barrier(0); x35 -= l8.x * x32; x35 -= l8.y * x33; x35 -= l8.z * x34; } __builtin_amdgcn_sched_barrier(0);
        float x36 = GDN_RHS(36); { const v4f l0 = GDN_L4(36, 0); const v4f l1 = GDN_L4(36, 1); const v4f l2 = GDN_L4(36, 2); const v4f l3 = GDN_L4(36, 3); const v4f l4 = GDN_L4(36, 4); const v4f l5 = GDN_L4(36, 5); const v4f l6 = GDN_L4(36, 6); const v4f l7 = GDN_L4(36, 7); __builtin_amdgcn_sched_barrier(0); x36 -= l0.x * x0; x36 -= l0.y * x1; x36 -= l0.z * x2; x36 -= l0.w * x3; x36 -= l1.x * x4; x36 -= l1.y * x5; x36 -= l1.z * x6; x36 -= l1.w * x7; x36 -= l2.x * x8; x36 -= l2.y * x9; x36 -= l2.z * x10; x36 -= l2.w * x11; x36 -= l3.x * x12; x36 -= l3.y * x13; x36 -= l3.z * x14; x36 -= l3.w * x15; x36 -= l4.x * x16; x36 -= l4.y * x17; x36 -= l4.z * x18; x36 -= l4.w * x19; x36 -= l5.x * x20; x36 -= l5.y * x21; x36 -= l5.z * x22; x36 -= l5.w * x23; x36 -= l6.x * x24; x36 -= l6.y * x25; x36 -= l6.z * x26; x36 -= l6.w * x27; x36 -= l7.x * x28; x36 -= l7.y * x29; x36 -= l7.z * x30; x36 -= l7.w * x31; } __builtin_amdgcn_sched_barrier(0); { const v4f l8 = GDN_L4(36, 8); __builtin_amdgcn_sched_barrier(0); x36 -= l8.x * x32; x36 -= l8.y * x33; x36 -= l8.z * x34; x36 -= l8.w * x35; } __builtin_amdgcn_sched_barrier(0);
        float x37 = GDN_RHS(37); { const v4f l0 = GDN_L4(37, 0); const v4f l1 = GDN_L4(37, 1); const v4f l2 = GDN_L4(37, 2); const v4f l3 = GDN_L4(37, 3); const v4f l4 = GDN_L4(37, 4); const v4f l5 = GDN_L4(37, 5); const v4f l6 = GDN_L4(37, 6); const v4f l7 = GDN_L4(37, 7); __builtin_amdgcn_sched_barrier(0); x37 -= l0.x * x0; x37 -= l0.y * x1; x37 -= l0.z * x2; x37 -= l0.w * x3; x37 -= l1.x * x4; x37 -= l1.y * x5; x37 -= l1.z * x6; x37 -= l1.w * x7; x37 -= l2.x * x8; x37 -= l2.y * x9; x37 -= l2.z * x10; x37 -= l2.w * x11; x37 -= l3.x * x12; x37 -= l3.y * x13; x37 -= l3.z * x14; x37 -= l3.w * x15; x37 -= l4.x * x16; x37 -= l4.y * x17; x37 -= l4.z * x18; x37 -= l4.w * x19; x37 -= l5.x * x20; x37 -= l5.y * x21; x37 -= l5.z * x22; x37 -= l5.w * x23; x37 -= l6.x * x24; x37 -= l6.y * x25; x37 -= l6.z * x26; x37 -= l6.w * x27; x37 -= l7.x * x28; x37 -= l7.y * x29; x37 -= l7.z * x30; x37 -= l7.w * x31; } __builtin_amdgcn_sched_barrier(0); { const v4f l8 = GDN_L4(37, 8); const v4f l9 = GDN_L4(37, 9); __builtin_amdgcn_sched_barrier(0); x37 -= l8.x * x32; x37 -= l8.y * x33; x37 -= l8.z * x34; x37 -= l8.w * x35; x37 -= l9.x * x36; } __builtin_amdgcn_sched_barrier(0);
        float x38 = GDN_RHS(38); { const v4f l0 = GDN_L4(38, 0); const v4f l1 = GDN_L4(38, 1); const v4f l2 = GDN_L4(38, 2); const v4f l3 = GDN_L4(38, 3); const v4f l4 = GDN_L4(38, 4); const v4f l5 = GDN_L4(38, 5); const v4f l6 = GDN_L4(38, 6); const v4f l7 = GDN_L4(38, 7); __builtin_amdgcn_sched_barrier(0); x38 -= l0.x * x0; x38 -= l0.y * x1; x38 -= l0.z * x2; x38 -= l0.w * x3; x38 -= l1.x * x4; x38 -= l1.y * x5; x38 -= l1.z * x6; x38 -= l1.w * x7; x38 -= l2.x * x8; x38 -= l2.y * x9; x38 -= l2.z * x10; x38 -= l2.w * x11; x38 -= l3.x * x12; x38 -= l3.y * x13; x38 -= l3.z * x14; x38 -= l3.w * x15; x38 -= l4.x * x16; x38 -= l4.y * x17; x38 -= l4.z * x18; x38 -= l4.w * x19; x38 -= l5.x * x20; x38 -= l5.y * x21; x38 -= l5.z * x22; x38 -= l5.w * x23; x38 -= l6.x * x24; x38 -= l6.y * x25; x38 -= l6.z * x26; x38 -= l6.w * x27; x38 -= l7.x * x28; x38 -= l7.y * x29; x38 -= l7.z * x30; x38 -= l7.w * x31; } __builtin_amdgcn_sched_barrier(0); { const v4f l8 = GDN_L4(38, 8); const v4f l9 = GDN_L4(38, 9); __builtin_amdgcn_sched_barrier(0); x38 -= l8.x * x32; x38 -= l8.y * x33; x38 -= l8.z * x34; x38 -= l8.w * x35; x38 -= l9.x * x36; x38 -= l9.y * x37; } __builtin_amdgcn_sched_barrier(0);
        float x39 = GDN_RHS(39); { const v4f l0 = GDN_L4(39, 0); const v4f l1 = GDN_L4(39, 1); const v4f l2 = GDN_L4(39, 2); const v4f l3 = GDN_L4(39, 3); const v4f l4 = GDN_L4(39, 4); const v4f l5 = GDN_L4(39, 5); const v4f l6 = GDN_L4(39, 6); const v4f l7 = GDN_L4(39, 7); __builtin_amdgcn_sched_barrier(0); x39 -= l0.x * x0; x39 -= l0.y * x1; x39 -= l0.z * x2; x39 -= l0.w * x3; x39 -= l1.x * x4; x39 -= l1.y * x5; x39 -= l1.z * x6; x39 -= l1.w * x7; x39 -= l2.x * x8; x39 -= l2.y * x9; x39 -= l2.z * x10; x39 -= l2.w * x11; x39 -= l3.x * x12; x39 -= l3.y * x13; x39 -= l3.z * x14; x39 -= l3.w * x15; x39 -= l4.x * x16; x39 -= l4.y * x17; x39 -= l4.z * x18; x39 -= l4.w * x19; x39 -= l5.x * x20; x39 -= l5.y * x21; x39 -= l5.z * x22; x39 -= l5.w * x23; x39 -= l6.x * x24; x39 -= l6.y * x25; x39 -= l6.z * x26; x39 -= l6.w * x27; x39 -= l7.x * x28; x39 -= l7.y * x29; x39 -= l7.z * x30; x39 -= l7.w * x31; } __builtin_amdgcn_sched_barrier(0); { const v4f l8 = GDN_L4(39, 8); const v4f l9 = GDN_L4(39, 9); __builtin_amdgcn_sched_barrier(0); x39 -= l8.x * x32; x39 -= l8.y * x33; x39 -= l8.z * x34; x39 -= l8.w * x35; x39 -= l9.x * x36; x39 -= l9.y * x37; x39 -= l9.z * x38; } __builtin_amdgcn_sched_barrier(0);
        float x40 = GDN_RHS(40); { const v4f l0 = GDN_L4(40, 0); const v4f l1 = GDN_L4(40, 1); const v4f l2 = GDN_L4(40, 2); const v4f l3 = GDN_L4(40, 3); const v4f l4 = GDN_L4(40, 4); const v4f l5 = GDN_L4(40, 5); const v4f l6 = GDN_L4(40, 6); const v4f l7 = GDN_L4(40, 7); __builtin_amdgcn_sched_barrier(0); x40 -= l0.x * x0; x40 -= l0.y * x1; x40 -= l0.z * x2; x40 -= l0.w * x3; x40 -= l1.x * x4; x40 -= l1.y * x5; x40 -= l1.z * x6; x40 -= l1.w * x7; x40 -= l2.x * x8; x40 -= l2.y * x9; x40 -= l2.z * x10; x40 -= l2.w * x11; x40 -= l3.x * x12; x40 -= l3.y * x13; x40 -= l3.z * x14; x40 -= l3.w * x15; x40 -= l4.x * x16; x40 -= l4.y * x17; x40 -= l4.z * x18; x40 -= l4.w * x19; x40 -= l5.x * x20; x40 -= l5.y * x21; x40 -= l5.z * x22; x40 -= l5.w * x23; x40 -= l6.x * x24; x40 -= l6.y * x25; x40 -= l6.z * x26; x40 -= l6.w * x27; x40 -= l7.x * x28; x40 -= l7.y * x29; x40 -= l7.z * x30; x40 -= l7.w * x31; } __builtin_amdgcn_sched_barrier(0); { const v4f l8 = GDN_L4(40, 8); const v4f l9 = GDN_L4(40, 9); __builtin_amdgcn_sched_barrier(0); x40 -= l8.x * x32; x40 -= l8.y * x33; x40 -= l8.z * x34; x40 -= l8.w * x35; x40 -= l9.x * x36; x40 -= l9.y * x37; x40 -= l9.z * x38; x40 -= l9.w * x39; } __builtin_amdgcn_sched_barrier(0);
        float x41 = GDN_RHS(41); { const v4f l0 = GDN_L4(41, 0); const v4f l1 = GDN_L4(41, 1); const v4f l2 = GDN_L4(41, 2); const v4f l3 = GDN_L4(41, 3); const v4f l4 = GDN_L4(41, 4); const v4f l5 = GDN_L4(41, 5); const v4f l6 = GDN_L4(41, 6); const v4f l7 = GDN_L4(41, 7); __builtin_amdgcn_sched_barrier(0); x41 -= l0.x * x0; x41 -= l0.y * x1; x41 -= l0.z * x2; x41 -= l0.w * x3; x41 -= l1.x * x4; x41 -= l1.y * x5; x41 -= l1.z * x6; x41 -= l1.w * x7; x41 -= l2.x * x8; x41 -= l2.y * x9; x41 -= l2.z * x10; x41 -= l2.w * x11; x41 -= l3.x * x12; x41 -= l3.y * x13; x41 -= l3.z * x14; x41 -= l3.w * x15; x41 -= l4.x * x16; x41 -= l4.y * x17; x41 -= l4.z * x18; x41 -= l4.w * x19; x41 -= l5.x * x20; x41 -= l5.y * x21; x41 -= l5.z * x22; x41 -= l5.w * x23; x41 -= l6.x * x24; x41 -= l6.y * x25; x41 -= l6.z * x26; x41 -= l6.w * x27; x41 -= l7.x * x28; x41 -= l7.y * x29; x41 -= l7.z * x30; x41 -= l7.w * x31; } __builtin_amdgcn_sched_barrier(0); { const v4f l8 = GDN_L4(41, 8); const v4f l9 = GDN_L4(41, 9); const v4f l10 = GDN_L4(41, 10); __builtin_amdgcn_sched_barrier(0); x41 -= l8.x * x32; x41 -= l8.y * x33; x41 -= l8.z * x34; x41 -= l8.w * x35; x41 -= l9.x * x36; x41 -= l9.y * x37; x41 -= l9.z * x38; x41 -= l9.w * x39; x41 -= l10.x * x40; } __builtin_amdgcn_sched_barrier(0);
        float x42 = GDN_RHS(42); { const v4f l0 = GDN_L4(42, 0); const v4f l1 = GDN_L4(42, 1); const v4f l2 = GDN_L4(42, 2); const v4f l3 = GDN_L4(42, 3); const v4f l4 = GDN_L4(42, 4); const v4f l5 = GDN_L4(42, 5); const v4f l6 = GDN_L4(42, 6); const v4f l7 = GDN_L4(42, 7); __builtin_amdgcn_sched_barrier(0); x42 -= l0.x * x0; x42 -= l0.y * x1; x42 -= l0.z * x2; x42 -= l0.w * x3; x42 -= l1.x * x4; x42 -= l1.y * x5; x42 -= l1.z * x6; x42 -= l1.w * x7; x42 -= l2.x * x8; x42 -= l2.y * x9; x42 -= l2.z * x10; x42 -= l2.w * x11; x42 -= l3.x * x12; x42 -= l3.y * x13; x42 -= l3.z * x14; x42 -= l3.w * x15; x42 -= l4.x * x16; x42 -= l4.y * x17; x42 -= l4.z * x18; x42 -= l4.w * x19; x42 -= l5.x * x20; x42 -= l5.y * x21; x42 -= l5.z * x22; x42 -= l5.w * x23; x42 -= l6.x * x24; x42 -= l6.y * x25; x42 -= l6.z * x26; x42 -= l6.w * x27; x42 -= l7.x * x28; x42 -= l7.y * x29; x42 -= l7.z * x30; x42 -= l7.w * x31; } __builtin_amdgcn_sched_barrier(0); { const v4f l8 = GDN_L4(42, 8); const v4f l9 = GDN_L4(42, 9); const v4f l10 = GDN_L4(42, 10); __builtin_amdgcn_sched_barrier(0); x42 -= l8.x * x32; x42 -= l8.y * x33; x42 -= l8.z * x34; x42 -= l8.w * x35; x42 -= l9.x * x36; x42 -= l9.y * x37; x42 -= l9.z * x38; x42 -= l9.w * x39; x42 -= l10.x * x40; x42 -= l10.y * x41; } __builtin_amdgcn_sched_barrier(0);
        float x43 = GDN_RHS(43); { const v4f l0 = GDN_L4(43, 0); const v4f l1 = GDN_L4(43, 1); const v4f l2 = GDN_L4(43, 2); const v4f l3 = GDN_L4(43, 3); const v4f l4 = GDN_L4(43, 4); const v4f l5 = GDN_L4(43, 5); const v4f l6 = GDN_L4(43, 6); const v4f l7 = GDN_L4(43, 7); __builtin_amdgcn_sched_barrier(0); x43 -= l0.x * x0; x43 -= l0.y * x1; x43 -= l0.z * x2; x43 -= l0.w * x3; x43 -= l1.x * x4; x43 -= l1.y * x5; x43 -= l1.z * x6; x43 -= l1.w * x7; x43 -= l2.x * x8; x43 -= l2.y * x9; x43 -= l2.z * x10; x43 -= l2.w * x11; x43 -= l3.x * x12; x43 -= l3.y * x13; x43 -= l3.z * x14; x43 -= l3.w * x15; x43 -= l4.x * x16; x43 -= l4.y * x17; x43 -= l4.z * x18; x43 -= l4.w * x19; x43 -= l5.x * x20; x43 -= l5.y * x21; x43 -= l5.z * x22; x43 -= l5.w * x23; x43 -= l6.x * x24; x43 -= l6.y * x25; x43 -= l6.z * x26; x43 -= l6.w * x27; x43 -= l7.x * x28; x43 -= l7.y * x29; x43 -= l7.z * x30; x43 -= l7.w * x31; } __builtin_amdgcn_sched_barrier(0); { const v4f l8 = GDN_L4(43, 8); const v4f l9 = GDN_L4(43, 9); const v4f l10 = GDN_L4(43, 10); __builtin_amdgcn_sched_barrier(0); x43 -= l8.x * x32; x43 -= l8.y * x33; x43 -= l8.z * x34; x43 -= l8.w * x35; x43 -= l9.x * x36; x43 -= l9.y * x37; x43 -= l9.z * x38; x43 -= l9.w * x39; x43 -= l10.x * x40; x43 -= l10.y * x41; x43 -= l10.z * x42; } __builtin_amdgcn_sched_barrier(0);
        float x44 = GDN_RHS(44); { const v4f l0 = GDN_L4(44, 0); const v4f l1 = GDN_L4(44, 1); const v4f l2 = GDN_L4(44, 2); const v4f l3 = GDN_L4(44, 3); const v4f l4 = GDN_L4(44, 4); const v4f l5 = GDN_L4(44, 5); const v4f l6 = GDN_L4(44, 6); const v4f l7 = GDN_L4(44, 7); __builtin_amdgcn_sched_barrier(0); x44 -= l0.x * x0; x44 -= l0.y * x1; x44 -= l0.z * x2; x44 -= l0.w * x3; x44 -= l1.x * x4; x44 -= l1.y * x5; x44 -= l1.z * x6; x44 -= l1.w * x7; x44 -= l2.x * x8; x44 -= l2.y * x9; x44 -= l2.z * x10; x44 -= l2.w * x11; x44 -= l3.x * x12; x44 -= l3.y * x13; x44 -= l3.z * x14; x44 -= l3.w * x15; x44 -= l4.x * x16; x44 -= l4.y * x17; x44 -= l4.z * x18; x44 -= l4.w * x19; x44 -= l5.x * x20; x44 -= l5.y * x21; x44 -= l5.z * x22; x44 -= l5.w * x23; x44 -= l6.x * x24; x44 -= l6.y * x25; x44 -= l6.z * x26; x44 -= l6.w * x27; x44 -= l7.x * x28; x44 -= l7.y * x29; x44 -= l7.z * x30; x44 -= l7.w * x31; } __builtin_amdgcn_sched_barrier(0); { const v4f l8 = GDN_L4(44, 8); const v4f l9 = GDN_L4(44, 9); const v4f l10 = GDN_L4(44, 10); __builtin_amdgcn_sched_barrier(0); x44 -= l8.x * x32; x44 -= l8.y * x33; x44 -= l8.z * x34; x44 -= l8.w * x35; x44 -= l9.x * x36; x44 -= l9.y * x37; x44 -= l9.z * x38; x44 -= l9.w * x39; x44 -= l10.x * x40; x44 -= l10.y * x41; x44 -= l10.z * x42; x44 -= l10.w * x43; } __builtin_amdgcn_sched_barrier(0);
        float x45 = GDN_RHS(45); { const v4f l0 = GDN_L4(45, 0); const v4f l1 = GDN_L4(45, 1); const v4f l2 = GDN_L4(45, 2); const v4f l3 = GDN_L4(45, 3); const v4f l4 = GDN_L4(45, 4); const v4f l5 = GDN_L4(45, 5); const v4f l6 = GDN_L4(45, 6); const v4f l7 = GDN_L4(45, 7); __builtin_amdgcn_sched_barrier(0); x45 -= l0.x * x0; x45 -= l0.y * x1; x45 -= l0.z * x2; x45 -= l0.w * x3; x45 -= l1.x * x4; x45 -= l1.y * x5; x45 -= l1.z * x6; x45 -= l1.w * x7; x45 -= l2.x * x8; x45 -= l2.y * x9; x45 -= l2.z * x10; x45 -= l2.w * x11; x45 -= l3.x * x12; x45 -= l3.y * x13; x45 -= l3.z * x14; x45 -= l3.w * x15; x45 -= l4.x * x16; x45 -= l4.y * x17; x45 -= l4.z * x18; x45 -= l4.w * x19; x45 -= l5.x * x20; x45 -= l5.y * x21; x45 -= l5.z * x22; x45 -= l5.w * x23; x45 -= l6.x * x24; x45 -= l6.y * x25; x45 -= l6.z * x26; x45 -= l6.w * x27; x45 -= l7.x * x28; x45 -= l7.y * x29; x45 -= l7.z * x30; x45 -= l7.w * x31; } __builtin_amdgcn_sched_barrier(0); { const v4f l8 = GDN_L4(45, 8); const v4f l9 = GDN_L4(45, 9); const v4f l10 = GDN_L4(45, 10); const v4f l11 = GDN_L4(45, 11); __builtin_amdgcn_sched_barrier(0); x45 -= l8.x * x32; x45 -= l8.y * x33; x45 -= l8.z * x34; x45 -= l8.w * x35; x45 -= l9.x * x36; x45 -= l9.y * x37; x45 -= l9.z * x38; x45 -= l9.w * x39; x45 -= l10.x * x40; x45 -= l10.y * x41; x45 -= l10.z * x42; x45 -= l10.w * x43; x45 -= l11.x * x44; } __builtin_amdgcn_sched_barrier(0);
        float x46 = GDN_RHS(46); { const v4f l0 = GDN_L4(46, 0); const v4f l1 = GDN_L4(46, 1); const v4f l2 = GDN_L4(46, 2); const v4f l3 = GDN_L4(46, 3); const v4f l4 = GDN_L4(46, 4); const v4f l5 = GDN_L4(46, 5); const v4f l6 = GDN_L4(46, 6); const v4f l7 = GDN_L4(46, 7); __builtin_amdgcn_sched_barrier(0); x46 -= l0.x * x0; x46 -= l0.y * x1; x46 -= l0.z * x2; x46 -= l0.w * x3; x46 -= l1.x * x4; x46 -= l1.y * x5; x46 -= l1.z * x6; x46 -= l1.w * x7; x46 -= l2.x * x8; x46 -= l2.y * x9; x46 -= l2.z * x10; x46 -= l2.w * x11; x46 -= l3.x * x12; x46 -= l3.y * x13; x46 -= l3.z * x14; x46 -= l3.w * x15; x46 -= l4.x * x16; x46 -= l4.y * x17; x46 -= l4.z * x18; x46 -= l4.w * x19; x46 -= l5.x * x20; x46 -= l5.y * x21; x46 -= l5.z * x22; x46 -= l5.w * x23; x46 -= l6.x * x24; x46 -= l6.y * x25; x46 -= l6.z * x26; x46 -= l6.w * x27; x46 -= l7.x * x28; x46 -= l7.y * x29; x46 -= l7.z * x30; x46 -= l7.w * x31; } __builtin_amdgcn_sched_barrier(0); { const v4f l8 = GDN_L4(46, 8); const v4f l9 = GDN_L4(46, 9); const v4f l10 = GDN_L4(46, 10); const v4f l11 = GDN_L4(46, 11); __builtin_amdgcn_sched_barrier(0); x46 -= l8.x * x32; x46 -= l8.y * x33; x46 -= l8.z * x34; x46 -= l8.w * x35; x46 -= l9.x * x36; x46 -= l9.y * x37; x46 -= l9.z * x38; x46 -= l9.w * x39; x46 -= l10.x * x40; x46 -= l10.y * x41; x46 -= l10.z * x42; x46 -= l10.w * x43; x46 -= l11.x * x44; x46 -= l11.y * x45; } __builtin_amdgcn_sched_barrier(0);
        float x47 = GDN_RHS(47); { const v4f l0 = GDN_L4(47, 0); const v4f l1 = GDN_L4(47, 1); const v4f l2 = GDN_L4(47, 2); const v4f l3 = GDN_L4(47, 3); const v4f l4 = GDN_L4(47, 4); const v4f l5 = GDN_L4(47, 5); const v4f l6 = GDN_L4(47, 6); const v4f l7 = GDN_L4(47, 7); __builtin_amdgcn_sched_barrier(0); x47 -= l0.x * x0; x47 -= l0.y * x1; x47 -= l0.z * x2; x47 -= l0.w * x3; x47 -= l1.x * x4; x47 -= l1.y * x5; x47 -= l1.z * x6; x47 -= l1.w * x7; x47 -= l2.x * x8; x47 -= l2.y * x9; x47 -= l2.z * x10; x47 -= l2.w * x11; x47 -= l3.x * x12; x47 -= l3.y * x13; x47 -= l3.z * x14; x47 -= l3.w * x15; x47 -= l4.x * x16; x47 -= l4.y * x17; x47 -= l4.z * x18; x47 -= l4.w * x19; x47 -= l5.x * x20; x47 -= l5.y * x21; x47 -= l5.z * x22; x47 -= l5.w * x23; x47 -= l6.x * x24; x47 -= l6.y * x25; x47 -= l6.z * x26; x47 -= l6.w * x27; x47 -= l7.x * x28; x47 -= l7.y * x29; x47 -= l7.z * x30; x47 -= l7.w * x31; } __builtin_amdgcn_sched_barrier(0); { const v4f l8 = GDN_L4(47, 8); const v4f l9 = GDN_L4(47, 9); const v4f l10 = GDN_L4(47, 10); const v4f l11 = GDN_L4(47, 11); __builtin_amdgcn_sched_barrier(0); x47 -= l8.x * x32; x47 -= l8.y * x33; x47 -= l8.z * x34; x47 -= l8.w * x35; x47 -= l9.x * x36; x47 -= l9.y * x37; x47 -= l9.z * x38; x47 -= l9.w * x39; x47 -= l10.x * x40; x47 -= l10.y * x41; x47 -= l10.z * x42; x47 -= l10.w * x43; x47 -= l11.x * x44; x47 -= l11.y * x45; x47 -= l11.z * x46; } __builtin_amdgcn_sched_barrier(0);
        float x48 = GDN_RHS(48); { const v4f l0 = GDN_L4(48, 0); const v4f l1 = GDN_L4(48, 1); const v4f l2 = GDN_L4(48, 2); const v4f l3 = GDN_L4(48, 3); const v4f l4 = GDN_L4(48, 4); const v4f l5 = GDN_L4(48, 5); const v4f l6 = GDN_L4(48, 6); const v4f l7 = GDN_L4(48, 7); __builtin_amdgcn_sched_barrier(0); x48 -= l0.x * x0; x48 -= l0.y * x1; x48 -= l0.z * x2; x48 -= l0.w * x3; x48 -= l1.x * x4; x48 -= l1.y * x5; x48 -= l1.z * x6; x48 -= l1.w * x7; x48 -= l2.x * x8; x48 -= l2.y * x9; x48 -= l2.z * x10; x48 -= l2.w * x11; x48 -= l3.x * x12; x48 -= l3.y * x13; x48 -= l3.z * x14; x48 -= l3.w * x15; x48 -= l4.x * x16; x48 -= l4.y * x17; x48 -= l4.z * x18; x48 -= l4.w * x19; x48 -= l5.x * x20; x48 -= l5.y * x21; x48 -= l5.z * x22; x48 -= l5.w * x23; x48 -= l6.x * x24; x48 -= l6.y * x25; x48 -= l6.z * x26; x48 -= l6.w * x27; x48 -= l7.x * x28; x48 -= l7.y * x29; x48 -= l7.z * x30; x48 -= l7.w * x31; } __builtin_amdgcn_sched_barrier(0); { const v4f l8 = GDN_L4(48, 8); const v4f l9 = GDN_L4(48, 9); const v4f l10 = GDN_L4(48, 10); const v4f l11 = GDN_L4(48, 11); __builtin_amdgcn_sched_barrier(0); x48 -= l8.x * x32; x48 -= l8.y * x33; x48 -= l8.z * x34; x48 -= l8.w * x35; x48 -= l9.x * x36; x48 -= l9.y * x37; x48 -= l9.z * x38; x48 -= l9.w * x39; x48 -= l10.x * x40; x48 -= l10.y * x41; x48 -= l10.z * x42; x48 -= l10.w * x43; x48 -= l11.x * x44; x48 -= l11.y * x45; x48 -= l11.z * x46; x48 -= l11.w * x47; } __builtin_amdgcn_sched_barrier(0);
        float x49 = GDN_RHS(49); { const v4f l0 = GDN_L4(49, 0); const v4f l1 = GDN_L4(49, 1); const v4f l2 = GDN_L4(49, 2); const v4f l3 = GDN_L4(49, 3); const v4f l4 = GDN_L4(49, 4); const v4f l5 = GDN_L4(49, 5); const v4f l6 = GDN_L4(49, 6); const v4f l7 = GDN_L4(49, 7); __builtin_amdgcn_sched_barrier(0); x49 -= l0.x * x0; x49 -= l0.y * x1; x49 -= l0.z * x2; x49 -= l0.w * x3; x49 -= l1.x * x4; x49 -= l1.y * x5; x49 -= l1.z * x6; x49 -= l1.w * x7; x49 -= l2.x * x8; x49 -= l2.y * x9; x49 -= l2.z * x10; x49 -= l2.w * x11; x49 -= l3.x * x12; x49 -= l3.y * x13; x49 -= l3.z * x14; x49 -= l3.w * x15; x49 -= l4.x * x16; x49 -= l4.y * x17; x49 -= l4.z * x18; x49 -= l4.w * x19; x49 -= l5.x * x20; x49 -= l5.y * x21; x49 -= l5.z * x22; x49 -= l5.w * x23; x49 -= l6.x * x24; x49 -= l6.y * x25; x49 -= l6.z * x26; x49 -= l6.w * x27; x49 -= l7.x * x28; x49 -= l7.y * x29; x49 -= l7.z * x30; x49 -= l7.w * x31; } __builtin_amdgcn_sched_barrier(0); { const v4f l8 = GDN_L4(49, 8); const v4f l9 = GDN_L4(49, 9); const v4f l10 = GDN_L4(49, 10); const v4f l11 = GDN_L4(49, 11); const v4f l12 = GDN_L4(49, 12); __builtin_amdgcn_sched_barrier(0); x49 -= l8.x * x32; x49 -= l8.y * x33; x49 -= l8.z * x34; x49 -= l8.w * x35; x49 -= l9.x * x36; x49 -= l9.y * x37; x49 -= l9.z * x38; x49 -= l9.w * x39; x49 -= l10.x * x40; x49 -= l10.y * x41; x49 -= l10.z * x42; x49 -= l10.w * x43; x49 -= l11.x * x44; x49 -= l11.y * x45; x49 -= l11.z * x46; x49 -= l11.w * x47; x49 -= l12.x * x48; } __builtin_amdgcn_sched_barrier(0);
        float x50 = GDN_RHS(50); { const v4f l0 = GDN_L4(50, 0); const v4f l1 = GDN_L4(50, 1); const v4f l2 = GDN_L4(50, 2); const v4f l3 = GDN_L4(50, 3); const v4f l4 = GDN_L4(50, 4); const v4f l5 = GDN_L4(50, 5); const v4f l6 = GDN_L4(50, 6); const v4f l7 = GDN_L4(50, 7); __builtin_amdgcn_sched_barrier(0); x50 -= l0.x * x0; x50 -= l0.y * x1; x50 -= l0.z * x2; x50 -= l0.w * x3; x50 -= l1.x * x4; x50 -= l1.y * x5; x50 -= l1.z * x6; x50 -= l1.w * x7; x50 -= l2.x * x8; x50 -= l2.y * x9; x50 -= l2.z * x10; x50 -= l2.w * x11; x50 -= l3.x * x12; x50 -= l3.y * x13; x50 -= l3.z * x14; x50 -= l3.w * x15; x50 -= l4.x * x16; x50 -= l4.y * x17; x50 -= l4.z * x18; x50 -= l4.w * x19; x50 -= l5.x * x20; x50 -= l5.y * x21; x50 -= l5.z * x22; x50 -= l5.w * x23; x50 -= l6.x * x24; x50 -= l6.y * x25; x50 -= l6.z * x26; x50 -= l6.w * x27; x50 -= l7.x * x28; x50 -= l7.y * x29; x50 -= l7.z * x30; x50 -= l7.w * x31; } __builtin_amdgcn_sched_barrier(0); { const v4f l8 = GDN_L4(50, 8); const v4f l9 = GDN_L4(50, 9); const v4f l10 = GDN_L4(50, 10); const v4f l11 = GDN_L4(50, 11); const v4f l12 = GDN_L4(50, 12); __builtin_amdgcn_sched_barrier(0); x50 -= l8.x * x32; x50 -= l8.y * x33; x50 -= l8.z * x34; x50 -= l8.w * x35; x50 -= l9.x * x36; x50 -= l9.y * x37; x50 -= l9.z * x38; x50 -= l9.w * x39; x50 -= l10.x * x40; x50 -= l10.y * x41; x50 -= l10.z * x42; x50 -= l10.w * x43; x50 -= l11.x * x44; x50 -= l11.y * x45; x50 -= l11.z * x46; x50 -= l11.w * x47; x50 -= l12.x * x48; x50 -= l12.y * x49; } __builtin_amdgcn_sched_barrier(0);
        float x51 = GDN_RHS(51); { const v4f l0 = GDN_L4(51, 0); const v4f l1 = GDN_L4(51, 1); const v4f l2 = GDN_L4(51, 2); const v4f l3 = GDN_L4(51, 3); const v4f l4 = GDN_L4(51, 4); const v4f l5 = GDN_L4(51, 5); const v4f l6 = GDN_L4(51, 6); const v4f l7 = GDN_L4(51, 7); __builtin_amdgcn_sched_barrier(0); x51 -= l0.x * x0; x51 -= l0.y * x1; x51 -= l0.z * x2; x51 -= l0.w * x3; x51 -= l1.x * x4; x51 -= l1.y * x5; x51 -= l1.z * x6; x51 -= l1.w * x7; x51 -= l2.x * x8; x51 -= l2.y * x9; x51 -= l2.z * x10; x51 -= l2.w * x11; x51 -= l3.x * x12; x51 -= l3.y * x13; x51 -= l3.z * x14; x51 -= l3.w * x15; x51 -= l4.x * x16; x51 -= l4.y * x17; x51 -= l4.z * x18; x51 -= l4.w * x19; x51 -= l5.x * x20; x51 -= l5.y * x21; x51 -= l5.z * x22; x51 -= l5.w * x23; x51 -= l6.x * x24; x51 -= l6.y * x25; x51 -= l6.z * x26; x51 -= l6.w * x27; x51 -= l7.x * x28; x51 -= l7.y * x29; x51 -= l7.z * x30; x51 -= l7.w * x31; } __builtin_amdgcn_sched_barrier(0); { const v4f l8 = GDN_L4(51, 8); const v4f l9 = GDN_L4(51, 9); const v4f l10 = GDN_L4(51, 10); const v4f l11 = GDN_L4(51, 11); const v4f l12 = GDN_L4(51, 12); __builtin_amdgcn_sched_barrier(0); x51 -= l8.x * x32; x51 -= l8.y * x33; x51 -= l8.z * x34; x51 -= l8.w * x35; x51 -= l9.x * x36; x51 -= l9.y * x37; x51 -= l9.z * x38; x51 -= l9.w * x39; x51 -= l10.x * x40; x51 -= l10.y * x41; x51 -= l10.z * x42; x51 -= l10.w * x43; x51 -= l11.x * x44; x51 -= l11.y * x45; x51 -= l11.z * x46; x51 -= l11.w * x47; x51 -= l12.x * x48; x51 -= l12.y * x49; x51 -= l12.z * x50; } __builtin_amdgcn_sched_barrier(0);
        float x52 = GDN_RHS(52); { const v4f l0 = GDN_L4(52, 0); const v4f l1 = GDN_L4(52, 1); const v4f l2 = GDN_L4(52, 2); const v4f l3 = GDN_L4(52, 3); const v4f l4 = GDN_L4(52, 4); const v4f l5 = GDN_L4(52, 5); const v4f l6 = GDN_L4(52, 6); const v4f l7 = GDN_L4(52, 7); __builtin_amdgcn_sched_barrier(0); x52 -= l0.x * x0; x52 -= l0.y * x1; x52 -= l0.z * x2; x52 -= l0.w * x3; x52 -= l1.x * x4; x52 -= l1.y * x5; x52 -= l1.z * x6; x52 -= l1.w * x7; x52 -= l2.x * x8; x52 -= l2.y * x9; x52 -= l2.z * x10; x52 -= l2.w * x11; x52 -= l3.x * x12; x52 -= l3.y * x13; x52 -= l3.z * x14; x52 -= l3.w * x15; x52 -= l4.x * x16; x52 -= l4.y * x17; x52 -= l4.z * x18; x52 -= l4.w * x19; x52 -= l5.x * x20; x52 -= l5.y * x21; x52 -= l5.z * x22; x52 -= l5.w * x23; x52 -= l6.x * x24; x52 -= l6.y * x25; x52 -= l6.z * x26; x52 -= l6.w * x27; x52 -= l7.x * x28; x52 -= l7.y * x29; x52 -= l7.z * x30; x52 -= l7.w * x31; } __builtin_amdgcn_sched_barrier(0); { const v4f l8 = GDN_L4(52, 8); const v4f l9 = GDN_L4(52, 9); const v4f l10 = GDN_L4(52, 10); const v4f l11 = GDN_L4(52, 11); const v4f l12 = GDN_L4(52, 12); __builtin_amdgcn_sched_barrier(0); x52 -= l8.x * x32; x52 -= l8.y * x33; x52 -= l8.z * x34; x52 -= l8.w * x35; x52 -= l9.x * x36; x52 -= l9.y * x37; x52 -= l9.z * x38; x52 -= l9.w * x39; x52 -= l10.x * x40; x52 -= l10.y * x41; x52 -= l10.z * x42; x52 -= l10.w * x43; x52 -= l11.x * x44; x52 -= l11.y * x45; x52 -= l11.z * x46; x52 -= l11.w * x47; x52 -= l12.x * x48; x52 -= l12.y * x49; x52 -= l12.z * x50; x52 -= l12.w * x51; } __builtin_amdgcn_sched_barrier(0);
        float x53 = GDN_RHS(53); { const v4f l0 = GDN_L4(53, 0); const v4f l1 = GDN_L4(53, 1); const v4f l2 = GDN_L4(53, 2); const v4f l3 = GDN_L4(53, 3); const v4f l4 = GDN_L4(53, 4); const v4f l5 = GDN_L4(53, 5); const v4f l6 = GDN_L4(53, 6); const v4f l7 = GDN_L4(53, 7); __builtin_amdgcn_sched_barrier(0); x53 -= l0.x * x0; x53 -= l0.y * x1; x53 -= l0.z * x2; x53 -= l0.w * x3; x53 -= l1.x * x4; x53 -= l1.y * x5; x53 -= l1.z * x6; x53 -= l1.w * x7; x53 -= l2.x * x8; x53 -= l2.y * x9; x53 -= l2.z * x10; x53 -= l2.w * x11; x53 -= l3.x * x12; x53 -= l3.y * x13; x53 -= l3.z * x14; x53 -= l3.w * x15; x53 -= l4.x * x16; x53 -= l4.y * x17; x53 -= l4.z * x18; x53 -= l4.w * x19; x53 -= l5.x * x20; x53 -= l5.y * x21; x53 -= l5.z * x22; x53 -= l5.w * x23; x53 -= l6.x * x24; x53 -= l6.y * x25; x53 -= l6.z * x26; x53 -= l6.w * x27; x53 -= l7.x * x28; x53 -= l7.y * x29; x53 -= l7.z * x30; x53 -= l7.w * x31; } __builtin_amdgcn_sched_barrier(0); { const v4f l8 = GDN_L4(53, 8); const v4f l9 = GDN_L4(53, 9); const v4f l10 = GDN_L4(53, 10); const v4f l11 = GDN_L4(53, 11); const v4f l12 = GDN_L4(53, 12); const v4f l13 = GDN_L4(53, 13); __builtin_amdgcn_sched_barrier(0); x53 -= l8.x * x32; x53 -= l8.y * x33; x53 -= l8.z * x34; x53 -= l8.w * x35; x53 -= l9.x * x36; x53 -= l9.y * x37; x53 -= l9.z * x38; x53 -= l9.w * x39; x53 -= l10.x * x40; x53 -= l10.y * x41; x53 -= l10.z * x42; x53 -= l10.w * x43; x53 -= l11.x * x44; x53 -= l11.y * x45; x53 -= l11.z * x46; x53 -= l11.w * x47; x53 -= l12.x * x48; x53 -= l12.y * x49; x53 -= l12.z * x50; x53 -= l12.w * x51; x53 -= l13.x * x52; } __builtin_amdgcn_sched_barrier(0);
        float x54 = GDN_RHS(54); { const v4f l0 = GDN_L4(54, 0); const v4f l1 = GDN_L4(54, 1); const v4f l2 = GDN_L4(54, 2); const v4f l3 = GDN_L4(54, 3); const v4f l4 = GDN_L4(54, 4); const v4f l5 = GDN_L4(54, 5); const v4f l6 = GDN_L4(54, 6); const v4f l7 = GDN_L4(54, 7); __builtin_amdgcn_sched_barrier(0); x54 -= l0.x * x0; x54 -= l0.y * x1; x54 -= l0.z * x2; x54 -= l0.w * x3; x54 -= l1.x * x4; x54 -= l1.y * x5; x54 -= l1.z * x6; x54 -= l1.w * x7; x54 -= l2.x * x8; x54 -= l2.y * x9; x54 -= l2.z * x10; x54 -= l2.w * x11; x54 -= l3.x * x12; x54 -= l3.y * x13; x54 -= l3.z * x14; x54 -= l3.w * x15; x54 -= l4.x * x16; x54 -= l4.y * x17; x54 -= l4.z * x18; x54 -= l4.w * x19; x54 -= l5.x * x20; x54 -= l5.y * x21; x54 -= l5.z * x22; x54 -= l5.w * x23; x54 -= l6.x * x24; x54 -= l6.y * x25; x54 -= l6.z * x26; x54 -= l6.w * x27; x54 -= l7.x * x28; x54 -= l7.y * x29; x54 -= l7.z * x30; x54 -= l7.w * x31; } __builtin_amdgcn_sched_barrier(0); { const v4f l8 = GDN_L4(54, 8); const v4f l9 = GDN_L4(54, 9); const v4f l10 = GDN_L4(54, 10); const v4f l11 = GDN_L4(54, 11); const v4f l12 = GDN_L4(54, 12); const v4f l13 = GDN_L4(54, 13); __builtin_amdgcn_sched_barrier(0); x54 -= l8.x * x32; x54 -= l8.y * x33; x54 -= l8.z * x34; x54 -= l8.w * x35; x54 -= l9.x * x36; x54 -= l9.y * x37; x54 -= l9.z * x38; x54 -= l9.w * x39; x54 -= l10.x * x40; x54 -= l10.y * x41; x54 -= l10.z * x42; x54 -= l10.w * x43; x54 -= l11.x * x44; x54 -= l11.y * x45; x54 -= l11.z * x46; x54 -= l11.w * x47; x54 -= l12.x * x48; x54 -= l12.y * x49; x54 -= l12.z * x50; x54 -= l12.w * x51; x54 -= l13.x * x52; x54 -= l13.y * x53; } __builtin_amdgcn_sched_barrier(0);
        float x55 = GDN_RHS(55); { const v4f l0 = GDN_L4(55, 0); const v4f l1 = GDN_L4(55, 1); const v4f l2 = GDN_L4(55, 2); const v4f l3 = GDN_L4(55, 3); const v4f l4 = GDN_L4(55, 4); const v4f l5 = GDN_L4(55, 5); const v4f l6 = GDN_L4(55, 6); const v4f l7 = GDN_L4(55, 7); __builtin_amdgcn_sched_barrier(0); x55 -= l0.x * x0; x55 -= l0.y * x1; x55 -= l0.z * x2; x55 -= l0.w * x3; x55 -= l1.x * x4; x55 -= l1.y * x5; x55 -= l1.z * x6; x55 -= l1.w * x7; x55 -= l2.x * x8; x55 -= l2.y * x9; x55 -= l2.z * x10; x55 -= l2.w * x11; x55 -= l3.x * x12; x55 -= l3.y * x13; x55 -= l3.z * x14; x55 -= l3.w * x15; x55 -= l4.x * x16; x55 -= l4.y * x17; x55 -= l4.z * x18; x55 -= l4.w * x19; x55 -= l5.x * x20; x55 -= l5.y * x21; x55 -= l5.z * x22; x55 -= l5.w * x23; x55 -= l6.x * x24; x55 -= l6.y * x25; x55 -= l6.z * x26; x55 -= l6.w * x27; x55 -= l7.x * x28; x55 -= l7.y * x29; x55 -= l7.z * x30; x55 -= l7.w * x31; } __builtin_amdgcn_sched_barrier(0); { const v4f l8 = GDN_L4(55, 8); const v4f l9 = GDN_L4(55, 9); const v4f l10 = GDN_L4(55, 10); const v4f l11 = GDN_L4(55, 11); const v4f l12 = GDN_L4(55, 12); const v4f l13 = GDN_L4(55, 13); __builtin_amdgcn_sched_barrier(0); x55 -= l8.x * x32; x55 -= l8.y * x33; x55 -= l8.z * x34; x55 -= l8.w * x35; x55 -= l9.x * x36; x55 -= l9.y * x37; x55 -= l9.z * x38; x55 -= l9.w * x39; x55 -= l10.x * x40; x55 -= l10.y * x41; x55 -= l10.z * x42; x55 -= l10.w * x43; x55 -= l11.x * x44; x55 -= l11.y * x45; x55 -= l11.z * x46; x55 -= l11.w * x47; x55 -= l12.x * x48; x55 -= l12.y * x49; x55 -= l12.z * x50; x55 -= l12.w * x51; x55 -= l13.x * x52; x55 -= l13.y * x53; x55 -= l13.z * x54; } __builtin_amdgcn_sched_barrier(0);
        float x56 = GDN_RHS(56); { const v4f l0 = GDN_L4(56, 0); const v4f l1 = GDN_L4(56, 1); const v4f l2 = GDN_L4(56, 2); const v4f l3 = GDN_L4(56, 3); const v4f l4 = GDN_L4(56, 4); const v4f l5 = GDN_L4(56, 5); const v4f l6 = GDN_L4(56, 6); const v4f l7 = GDN_L4(56, 7); __builtin_amdgcn_sched_barrier(0); x56 -= l0.x * x0; x56 -= l0.y * x1; x56 -= l0.z * x2; x56 -= l0.w * x3; x56 -= l1.x * x4; x56 -= l1.y * x5; x56 -= l1.z * x6; x56 -= l1.w * x7; x56 -= l2.x * x8; x56 -= l2.y * x9; x56 -= l2.z * x10; x56 -= l2.w * x11; x56 -= l3.x * x12; x56 -= l3.y * x13; x56 -= l3.z * x14; x56 -= l3.w * x15; x56 -= l4.x * x16; x56 -= l4.y * x17; x56 -= l4.z * x18; x56 -= l4.w * x19; x56 -= l5.x * x20; x56 -= l5.y * x21; x56 -= l5.z * x22; x56 -= l5.w * x23; x56 -= l6.x * x24; x56 -= l6.y * x25; x56 -= l6.z * x26; x56 -= l6.w * x27; x56 -= l7.x * x28; x56 -= l7.y * x29; x56 -= l7.z * x30; x56 -= l7.w * x31; } __builtin_amdgcn_sched_barrier(0); { const v4f l8 = GDN_L4(56, 8); const v4f l9 = GDN_L4(56, 9); const v4f l10 = GDN_L4(56, 10); const v4f l11 = GDN_L4(56, 11); const v4f l12 = GDN_L4(56, 12); const v4f l13 = GDN_L4(56, 13); __builtin_amdgcn_sched_barrier(0); x56 -= l8.x * x32; x56 -= l8.y * x33; x56 -= l8.z * x34; x56 -= l8.w * x35; x56 -= l9.x * x36; x56 -= l9.y * x37; x56 -= l9.z * x38; x56 -= l9.w * x39; x56 -= l10.x * x40; x56 -= l10.y * x41; x56 -= l10.z * x42; x56 -= l10.w * x43; x56 -= l11.x * x44; x56 -= l11.y * x45; x56 -= l11.z * x46; x56 -= l11.w * x47; x56 -= l12.x * x48; x56 -= l12.y * x49; x56 -= l12.z * x50; x56 -= l12.w * x51; x56 -= l13.x * x52; x56 -= l13.y * x53; x56 -= l13.z * x54; x56 -= l13.w * x55; } __builtin_amdgcn_sched_barrier(0);
        float x57 = GDN_RHS(57); { const v4f l0 = GDN_L4(57, 0); const v4f l1 = GDN_L4(57, 1); const v4f l2 = GDN_L4(57, 2); const v4f l3 = GDN_L4(57, 3); const v4f l4 = GDN_L4(57, 4); const v4f l5 = GDN_L4(57, 5); const v4f l6 = GDN_L4(57, 6); const v4f l7 = GDN_L4(57, 7); __builtin_amdgcn_sched_barrier(0); x57 -= l0.x * x0; x57 -= l0.y * x1; x57 -= l0.z * x2; x57 -= l0.w * x3; x57 -= l1.x * x4; x57 -= l1.y * x5; x57 -= l1.z * x6; x57 -= l1.w * x7; x57 -= l2.x * x8; x57 -= l2.y * x9; x57 -= l2.z * x10; x57 -= l2.w * x11; x57 -= l3.x * x12; x57 -= l3.y * x13; x57 -= l3.z * x14; x57 -= l3.w * x15; x57 -= l4.x * x16; x57 -= l4.y * x17; x57 -= l4.z * x18; x57 -= l4.w * x19; x57 -= l5.x * x20; x57 -= l5.y * x21; x57 -= l5.z * x22; x57 -= l5.w * x23; x57 -= l6.x * x24; x57 -= l6.y * x25; x57 -= l6.z * x26; x57 -= l6.w * x27; x57 -= l7.x * x28; x57 -= l7.y * x29; x57 -= l7.z * x30; x57 -= l7.w * x31; } __builtin_amdgcn_sched_barrier(0); { const v4f l8 = GDN_L4(57, 8); const v4f l9 = GDN_L4(57, 9); const v4f l10 = GDN_L4(57, 10); const v4f l11 = GDN_L4(57, 11); const v4f l12 = GDN_L4(57, 12); const v4f l13 = GDN_L4(57, 13); const v4f l14 = GDN_L4(57, 14); __builtin_amdgcn_sched_barrier(0); x57 -= l8.x * x32; x57 -= l8.y * x33; x57 -= l8.z * x34; x57 -= l8.w * x35; x57 -= l9.x * x36; x57 -= l9.y * x37; x57 -= l9.z * x38; x57 -= l9.w * x39; x57 -= l10.x * x40; x57 -= l10.y * x41; x57 -= l10.z * x42; x57 -= l10.w * x43; x57 -= l11.x * x44; x57 -= l11.y * x45; x57 -= l11.z * x46; x57 -= l11.w * x47; x57 -= l12.x * x48; x57 -= l12.y * x49; x57 -= l12.z * x50; x57 -= l12.w * x51; x57 -= l13.x * x52; x57 -= l13.y * x53; x57 -= l13.z * x54; x57 -= l13.w * x55; x57 -= l14.x * x56; } __builtin_amdgcn_sched_barrier(0);
        float x58 = GDN_RHS(58); { const v4f l0 = GDN_L4(58, 0); const v4f l1 = GDN_L4(58, 1); const v4f l2 = GDN_L4(58, 2); const v4f l3 = GDN_L4(58, 3); const v4f l4 = GDN_L4(58, 4); const v4f l5 = GDN_L4(58, 5); const v4f l6 = GDN_L4(58, 6); const v4f l7 = GDN_L4(58, 7); __builtin_amdgcn_sched_barrier(0); x58 -= l0.x * x0; x58 -= l0.y * x1; x58 -= l0.z * x2; x58 -= l0.w * x3; x58 -= l1.x * x4; x58 -= l1.y * x5; x58 -= l1.z * x6; x58 -= l1.w * x7; x58 -= l2.x * x8; x58 -= l2.y * x9; x58 -= l2.z * x10; x58 -= l2.w * x11; x58 -= l3.x * x12; x58 -= l3.y * x13; x58 -= l3.z * x14; x58 -= l3.w * x15; x58 -= l4.x * x16; x58 -= l4.y * x17; x58 -= l4.z * x18; x58 -= l4.w * x19; x58 -= l5.x * x20; x58 -= l5.y * x21; x58 -= l5.z * x22; x58 -= l5.w * x23; x58 -= l6.x * x24; x58 -= l6.y * x25; x58 -= l6.z * x26; x58 -= l6.w * x27; x58 -= l7.x * x28; x58 -= l7.y * x29; x58 -= l7.z * x30; x58 -= l7.w * x31; } __builtin_amdgcn_sched_barrier(0); { const v4f l8 = GDN_L4(58, 8); const v4f l9 = GDN_L4(58, 9); const v4f l10 = GDN_L4(58, 10); const v4f l11 = GDN_L4(58, 11); const v4f l12 = GDN_L4(58, 12); const v4f l13 = GDN_L4(58, 13); const v4f l14 = GDN_L4(58, 14); __builtin_amdgcn_sched_barrier(0); x58 -= l8.x * x32; x58 -= l8.y * x33; x58 -= l8.z * x34; x58 -= l8.w * x35; x58 -= l9.x * x36; x58 -= l9.y * x37; x58 -= l9.z * x38; x58 -= l9.w * x39; x58 -= l10.x * x40; x58 -= l10.y * x41; x58 -= l10.z * x42; x58 -= l10.w * x43; x58 -= l11.x * x44; x58 -= l11.y * x45; x58 -= l11.z * x46; x58 -= l11.w * x47; x58 -= l12.x * x48; x58 -= l12.y * x49; x58 -= l12.z * x50; x58 -= l12.w * x51; x58 -= l13.x * x52; x58 -= l13.y * x53; x58 -= l13.z * x54; x58 -= l13.w * x55; x58 -= l14.x * x56; x58 -= l14.y * x57; } __builtin_amdgcn_sched_barrier(0);
        float x59 = GDN_RHS(59); { const v4f l0 = GDN_L4(59, 0); const v4f l1 = GDN_L4(59, 1); const v4f l2 = GDN_L4(59, 2); const v4f l3 = GDN_L4(59, 3); const v4f l4 = GDN_L4(59, 4); const v4f l5 = GDN_L4(59, 5); const v4f l6 = GDN_L4(59, 6); const v4f l7 = GDN_L4(59, 7); __builtin_amdgcn_sched_barrier(0); x59 -= l0.x * x0; x59 -= l0.y * x1; x59 -= l0.z * x2; x59 -= l0.w * x3; x59 -= l1.x * x4; x59 -= l1.y * x5; x59 -= l1.z * x6; x59 -= l1.w * x7; x59 -= l2.x * x8; x59 -= l2.y * x9; x59 -= l2.z * x10; x59 -= l2.w * x11; x59 -= l3.x * x12; x59 -= l3.y * x13; x59 -= l3.z * x14; x59 -= l3.w * x15; x59 -= l4.x * x16; x59 -= l4.y * x17; x59 -= l4.z * x18; x59 -= l4.w * x19; x59 -= l5.x * x20; x59 -= l5.y * x21; x59 -= l5.z * x22; x59 -= l5.w * x23; x59 -= l6.x * x24; x59 -= l6.y * x25; x59 -= l6.z * x26; x59 -= l6.w * x27; x59 -= l7.x * x28; x59 -= l7.y * x29; x59 -= l7.z * x30; x59 -= l7.w * x31; } __builtin_amdgcn_sched_barrier(0); { const v4f l8 = GDN_L4(59, 8); const v4f l9 = GDN_L4(59, 9); const v4f l10 = GDN_L4(59, 10); const v4f l11 = GDN_L4(59, 11); const v4f l12 = GDN_L4(59, 12); const v4f l13 = GDN_L4(59, 13); const v4f l14 = GDN_L4(59, 14); __builtin_amdgcn_sched_barrier(0); x59 -= l8.x * x32; x59 -= l8.y * x33; x59 -= l8.z * x34; x59 -= l8.w * x35; x59 -= l9.x * x36; x59 -= l9.y * x37; x59 -= l9.z * x38; x59 -= l9.w * x39; x59 -= l10.x * x40; x59 -= l10.y * x41; x59 -= l10.z * x42; x59 -= l10.w * x43; x59 -= l11.x * x44; x59 -= l11.y * x45; x59 -= l11.z * x46; x59 -= l11.w * x47; x59 -= l12.x * x48; x59 -= l12.y * x49; x59 -= l12.z * x50; x59 -= l12.w * x51; x59 -= l13.x * x52; x59 -= l13.y * x53; x59 -= l13.z * x54; x59 -= l13.w * x55; x59 -= l14.x * x56; x59 -= l14.y * x57; x59 -= l14.z * x58; } __builtin_amdgcn_sched_barrier(0);
        float x60 = GDN_RHS(60); { const v4f l0 = GDN_L4(60, 0); const v4f l1 = GDN_L4(60, 1); const v4f l2 = GDN_L4(60, 2); const v4f l3 = GDN_L4(60, 3); const v4f l4 = GDN_L4(60, 4); const v4f l5 = GDN_L4(60, 5); const v4f l6 = GDN_L4(60, 6); const v4f l7 = GDN_L4(60, 7); __builtin_amdgcn_sched_barrier(0); x60 -= l0.x * x0; x60 -= l0.y * x1; x60 -= l0.z * x2; x60 -= l0.w * x3; x60 -= l1.x * x4; x60 -= l1.y * x5; x60 -= l1.z * x6; x60 -= l1.w * x7; x60 -= l2.x * x8; x60 -= l2.y * x9; x60 -= l2.z * x10; x60 -= l2.w * x11; x60 -= l3.x * x12; x60 -= l3.y * x13; x60 -= l3.z * x14; x60 -= l3.w * x15; x60 -= l4.x * x16; x60 -= l4.y * x17; x60 -= l4.z * x18; x60 -= l4.w * x19; x60 -= l5.x * x20; x60 -= l5.y * x21; x60 -= l5.z * x22; x60 -= l5.w * x23; x60 -= l6.x * x24; x60 -= l6.y * x25; x60 -= l6.z * x26; x60 -= l6.w * x27; x60 -= l7.x * x28; x60 -= l7.y * x29; x60 -= l7.z * x30; x60 -= l7.w * x31; } __builtin_amdgcn_sched_barrier(0); { const v4f l8 = GDN_L4(60, 8); const v4f l9 = GDN_L4(60, 9); const v4f l10 = GDN_L4(60, 10); const v4f l11 = GDN_L4(60, 11); const v4f l12 = GDN_L4(60, 12); const v4f l13 = GDN_L4(60, 13); const v4f l14 = GDN_L4(60, 14); __builtin_amdgcn_sched_barrier(0); x60 -= l8.x * x32; x60 -= l8.y * x33; x60 -= l8.z * x34; x60 -= l8.w * x35; x60 -= l9.x * x36; x60 -= l9.y * x37; x60 -= l9.z * x38; x60 -= l9.w * x39; x60 -= l10.x * x40; x60 -= l10.y * x41; x60 -= l10.z * x42; x60 -= l10.w * x43; x60 -= l11.x * x44; x60 -= l11.y * x45; x60 -= l11.z * x46; x60 -= l11.w * x47; x60 -= l12.x * x48; x60 -= l12.y * x49; x60 -= l12.z * x50; x60 -= l12.w * x51; x60 -= l13.x * x52; x60 -= l13.y * x53; x60 -= l13.z * x54; x60 -= l13.w * x55; x60 -= l14.x * x56; x60 -= l14.y * x57; x60 -= l14.z * x58; x60 -= l14.w * x59; } __builtin_amdgcn_sched_barrier(0);
        float x61 = GDN_RHS(61); { const v4f l0 = GDN_L4(61, 0); const v4f l1 = GDN_L4(61, 1); const v4f l2 = GDN_L4(61, 2); const v4f l3 = GDN_L4(61, 3); const v4f l4 = GDN_L4(61, 4); const v4f l5 = GDN_L4(61, 5); const v4f l6 = GDN_L4(61, 6); const v4f l7 = GDN_L4(61, 7); __builtin_amdgcn_sched_barrier(0); x61 -= l0.x * x0; x61 -= l0.y * x1; x61 -= l0.z * x2; x61 -= l0.w * x3; x61 -= l1.x * x4; x61 -= l1.y * x5; x61 -= l1.z * x6; x61 -= l1.w * x7; x61 -= l2.x * x8; x61 -= l2.y * x9; x61 -= l2.z * x10; x61 -= l2.w * x11; x61 -= l3.x * x12; x61 -= l3.y * x13; x61 -= l3.z * x14; x61 -= l3.w * x15; x61 -= l4.x * x16; x61 -= l4.y * x17; x61 -= l4.z * x18; x61 -= l4.w * x19; x61 -= l5.x * x20; x61 -= l5.y * x21; x61 -= l5.z * x22; x61 -= l5.w * x23; x61 -= l6.x * x24; x61 -= l6.y * x25; x61 -= l6.z * x26; x61 -= l6.w * x27; x61 -= l7.x * x28; x61 -= l7.y * x29; x61 -= l7.z * x30; x61 -= l7.w * x31; } __builtin_amdgcn_sched_barrier(0); { const v4f l8 = GDN_L4(61, 8); const v4f l9 = GDN_L4(61, 9); const v4f l10 = GDN_L4(61, 10); const v4f l11 = GDN_L4(61, 11); const v4f l12 = GDN_L4(61, 12); const v4f l13 = GDN_L4(61, 13); const v4f l14 = GDN_L4(61, 14); const v4f l15 = GDN_L4(61, 15); __builtin_amdgcn_sched_barrier(0); x61 -= l8.x * x32; x61 -= l8.y * x33; x61 -= l8.z * x34; x61 -= l8.w * x35; x61 -= l9.x * x36; x61 -= l9.y * x37; x61 -= l9.z * x38; x61 -= l9.w * x39; x61 -= l10.x * x40; x61 -= l10.y * x41; x61 -= l10.z * x42; x61 -= l10.w * x43; x61 -= l11.x * x44; x61 -= l11.y * x45; x61 -= l11.z * x46; x61 -= l11.w * x47; x61 -= l12.x * x48; x61 -= l12.y * x49; x61 -= l12.z * x50; x61 -= l12.w * x51; x61 -= l13.x * x52; x61 -= l13.y * x53; x61 -= l13.z * x54; x61 -= l13.w * x55; x61 -= l14.x * x56; x61 -= l14.y * x57; x61 -= l14.z * x58; x61 -= l14.w * x59; x61 -= l15.x * x60; } __builtin_amdgcn_sched_barrier(0);
        float x62 = GDN_RHS(62); { const v4f l0 = GDN_L4(62, 0); const v4f l1 = GDN_L4(62, 1); const v4f l2 = GDN_L4(62, 2); const v4f l3 = GDN_L4(62, 3); const v4f l4 = GDN_L4(62, 4); const v4f l5 = GDN_L4(62, 5); const v4f l6 = GDN_L4(62, 6); const v4f l7 = GDN_L4(62, 7); __builtin_amdgcn_sched_barrier(0); x62 -= l0.x * x0; x62 -= l0.y * x1; x62 -= l0.z * x2; x62 -= l0.w * x3; x62 -= l1.x * x4; x62 -= l1.y * x5; x62 -= l1.z * x6; x62 -= l1.w * x7; x62 -= l2.x * x8; x62 -= l2.y * x9; x62 -= l2.z * x10; x62 -= l2.w * x11; x62 -= l3.x * x12; x62 -= l3.y * x13; x62 -= l3.z * x14; x62 -= l3.w * x15; x62 -= l4.x * x16; x62 -= l4.y * x17; x62 -= l4.z * x18; x62 -= l4.w * x19; x62 -= l5.x * x20; x62 -= l5.y * x21; x62 -= l5.z * x22; x62 -= l5.w * x23; x62 -= l6.x * x24; x62 -= l6.y * x25; x62 -= l6.z * x26; x62 -= l6.w * x27; x62 -= l7.x * x28; x62 -= l7.y * x29; x62 -= l7.z * x30; x62 -= l7.w * x31; } __builtin_amdgcn_sched_barrier(0); { const v4f l8 = GDN_L4(62, 8); const v4f l9 = GDN_L4(62, 9); const v4f l10 = GDN_L4(62, 10); const v4f l11 = GDN_L4(62, 11); const v4f l12 = GDN_L4(62, 12); const v4f l13 = GDN_L4(62, 13); const v4f l14 = GDN_L4(62, 14); const v4f l15 = GDN_L4(62, 15); __builtin_amdgcn_sched_barrier(0); x62 -= l8.x * x32; x62 -= l8.y * x33; x62 -= l8.z * x34; x62 -= l8.w * x35; x62 -= l9.x * x36; x62 -= l9.y * x37; x62 -= l9.z * x38; x62 -= l9.w * x39; x62 -= l10.x * x40; x62 -= l10.y * x41; x62 -= l10.z * x42; x62 -= l10.w * x43; x62 -= l11.x * x44; x62 -= l11.y * x45; x62 -= l11.z * x46; x62 -= l11.w * x47; x62 -= l12.x * x48; x62 -= l12.y * x49; x62 -= l12.z * x50; x62 -= l12.w * x51; x62 -= l13.x * x52; x62 -= l13.y * x53; x62 -= l13.z * x54; x62 -= l13.w * x55; x62 -= l14.x * x56; x62 -= l14.y * x57; x62 -= l14.z * x58; x62 -= l14.w * x59; x62 -= l15.x * x60; x62 -= l15.y * x61; } __builtin_amdgcn_sched_barrier(0);
        float x63 = GDN_RHS(63); { const v4f l0 = GDN_L4(63, 0); const v4f l1 = GDN_L4(63, 1); const v4f l2 = GDN_L4(63, 2); const v4f l3 = GDN_L4(63, 3); const v4f l4 = GDN_L4(63, 4); const v4f l5 = GDN_L4(63, 5); const v4f l6 = GDN_L4(63, 6); const v4f l7 = GDN_L4(63, 7); __builtin_amdgcn_sched_barrier(0); x63 -= l0.x * x0; x63 -= l0.y * x1; x63 -= l0.z * x2; x63 -= l0.w * x3; x63 -= l1.x * x4; x63 -= l1.y * x5; x63 -= l1.z * x6; x63 -= l1.w * x7; x63 -= l2.x * x8; x63 -= l2.y * x9; x63 -= l2.z * x10; x63 -= l2.w * x11; x63 -= l3.x * x12; x63 -= l3.y * x13; x63 -= l3.z * x14; x63 -= l3.w * x15; x63 -= l4.x * x16; x63 -= l4.y * x17; x63 -= l4.z * x18; x63 -= l4.w * x19; x63 -= l5.x * x20; x63 -= l5.y * x21; x63 -= l5.z * x22; x63 -= l5.w * x23; x63 -= l6.x * x24; x63 -= l6.y * x25; x63 -= l6.z * x26; x63 -= l6.w * x27; x63 -= l7.x * x28; x63 -= l7.y * x29; x63 -= l7.z * x30; x63 -= l7.w * x31; } __builtin_amdgcn_sched_barrier(0); { const v4f l8 = GDN_L4(63, 8); const v4f l9 = GDN_L4(63, 9); const v4f l10 = GDN_L4(63, 10); const v4f l11 = GDN_L4(63, 11); const v4f l12 = GDN_L4(63, 12); const v4f l13 = GDN_L4(63, 13); const v4f l14 = GDN_L4(63, 14); const v4f l15 = GDN_L4(63, 15); __builtin_amdgcn_sched_barrier(0); x63 -= l8.x * x32; x63 -= l8.y * x33; x63 -= l8.z * x34; x63 -= l8.w * x35; x63 -= l9.x * x36; x63 -= l9.y * x37; x63 -= l9.z * x38; x63 -= l9.w * x39; x63 -= l10.x * x40; x63 -= l10.y * x41; x63 -= l10.z * x42; x63 -= l10.w * x43; x63 -= l11.x * x44; x63 -= l11.y * x45; x63 -= l11.z * x46; x63 -= l11.w * x47; x63 -= l12.x * x48; x63 -= l12.y * x49; x63 -= l12.z * x50; x63 -= l12.w * x51; x63 -= l13.x * x52; x63 -= l13.y * x53; x63 -= l13.z * x54; x63 -= l13.w * x55; x63 -= l14.x * x56; x63 -= l14.y * x57; x63 -= l14.z * x58; x63 -= l14.w * x59; x63 -= l15.x * x60; x63 -= l15.y * x61; x63 -= l15.z * x62; } __builtin_amdgcn_sched_barrier(0);
        if (c < 128) { GU[0 * 128 + c] = x0; GU[1 * 128 + c] = x1; GU[2 * 128 + c] = x2; GU[3 * 128 + c] = x3; GU[4 * 128 + c] = x4; GU[5 * 128 + c] = x5; GU[6 * 128 + c] = x6; GU[7 * 128 + c] = x7; GU[8 * 128 + c] = x8; GU[9 * 128 + c] = x9; GU[10 * 128 + c] = x10; GU[11 * 128 + c] = x11; GU[12 * 128 + c] = x12; GU[13 * 128 + c] = x13; GU[14 * 128 + c] = x14; GU[15 * 128 + c] = x15; GU[16 * 128 + c] = x16; GU[17 * 128 + c] = x17; GU[18 * 128 + c] = x18; GU[19 * 128 + c] = x19; GU[20 * 128 + c] = x20; GU[21 * 128 + c] = x21; GU[22 * 128 + c] = x22; GU[23 * 128 + c] = x23; GU[24 * 128 + c] = x24; GU[25 * 128 + c] = x25; GU[26 * 128 + c] = x26; GU[27 * 128 + c] = x27; GU[28 * 128 + c] = x28; GU[29 * 128 + c] = x29; GU[30 * 128 + c] = x30; GU[31 * 128 + c] = x31; GU[32 * 128 + c] = x32; GU[33 * 128 + c] = x33; GU[34 * 128 + c] = x34; GU[35 * 128 + c] = x35; GU[36 * 128 + c] = x36; GU[37 * 128 + c] = x37; GU[38 * 128 + c] = x38; GU[39 * 128 + c] = x39; GU[40 * 128 + c] = x40; GU[41 * 128 + c] = x41; GU[42 * 128 + c] = x42; GU[43 * 128 + c] = x43; GU[44 * 128 + c] = x44; GU[45 * 128 + c] = x45; GU[46 * 128 + c] = x46; GU[47 * 128 + c] = x47; GU[48 * 128 + c] = x48; GU[49 * 128 + c] = x49; GU[50 * 128 + c] = x50; GU[51 * 128 + c] = x51; GU[52 * 128 + c] = x52; GU[53 * 128 + c] = x53; GU[54 * 128 + c] = x54; GU[55 * 128 + c] = x55; GU[56 * 128 + c] = x56; GU[57 * 128 + c] = x57; GU[58 * 128 + c] = x58; GU[59 * 128 + c] = x59; GU[60 * 128 + c] = x60; GU[61 * 128 + c] = x61; GU[62 * 128 + c] = x62; GU[63 * 128 + c] = x63; }
        else { GNW[0 * 128 + (c - 128)] = (bf16)f2bf(-x0); GNW[1 * 128 + (c - 128)] = (bf16)f2bf(-x1); GNW[2 * 128 + (c - 128)] = (bf16)f2bf(-x2); GNW[3 * 128 + (c - 128)] = (bf16)f2bf(-x3); GNW[4 * 128 + (c - 128)] = (bf16)f2bf(-x4); GNW[5 * 128 + (c - 128)] = (bf16)f2bf(-x5); GNW[6 * 128 + (c - 128)] = (bf16)f2bf(-x6); GNW[7 * 128 + (c - 128)] = (bf16)f2bf(-x7); GNW[8 * 128 + (c - 128)] = (bf16)f2bf(-x8); GNW[9 * 128 + (c - 128)] = (bf16)f2bf(-x9); GNW[10 * 128 + (c - 128)] = (bf16)f2bf(-x10); GNW[11 * 128 + (c - 128)] = (bf16)f2bf(-x11); GNW[12 * 128 + (c - 128)] = (bf16)f2bf(-x12); GNW[13 * 128 + (c - 128)] = (bf16)f2bf(-x13); GNW[14 * 128 + (c - 128)] = (bf16)f2bf(-x14); GNW[15 * 128 + (c - 128)] = (bf16)f2bf(-x15); GNW[16 * 128 + (c - 128)] = (bf16)f2bf(-x16); GNW[17 * 128 + (c - 128)] = (bf16)f2bf(-x17); GNW[18 * 128 + (c - 128)] = (bf16)f2bf(-x18); GNW[19 * 128 + (c - 128)] = (bf16)f2bf(-x19); GNW[20 * 128 + (c - 128)] = (bf16)f2bf(-x20); GNW[21 * 128 + (c - 128)] = (bf16)f2bf(-x21); GNW[22 * 128 + (c - 128)] = (bf16)f2bf(-x22); GNW[23 * 128 + (c - 128)] = (bf16)f2bf(-x23); GNW[24 * 128 + (c - 128)] = (bf16)f2bf(-x24); GNW[25 * 128 + (c - 128)] = (bf16)f2bf(-x25); GNW[26 * 128 + (c - 128)] = (bf16)f2bf(-x26); GNW[27 * 128 + (c - 128)] = (bf16)f2bf(-x27); GNW[28 * 128 + (c - 128)] = (bf16)f2bf(-x28); GNW[29 * 128 + (c - 128)] = (bf16)f2bf(-x29); GNW[30 * 128 + (c - 128)] = (bf16)f2bf(-x30); GNW[31 * 128 + (c - 128)] = (bf16)f2bf(-x31); GNW[32 * 128 + (c - 128)] = (bf16)f2bf(-x32); GNW[33 * 128 + (c - 128)] = (bf16)f2bf(-x33); GNW[34 * 128 + (c - 128)] = (bf16)f2bf(-x34); GNW[35 * 128 + (c - 128)] = (bf16)f2bf(-x35); GNW[36 * 128 + (c - 128)] = (bf16)f2bf(-x36); GNW[37 * 128 + (c - 128)] = (bf16)f2bf(-x37); GNW[38 * 128 + (c - 128)] = (bf16)f2bf(-x38); GNW[39 * 128 + (c - 128)] = (bf16)f2bf(-x39); GNW[40 * 128 + (c - 128)] = (bf16)f2bf(-x40); GNW[41 * 128 + (c - 128)] = (bf16)f2bf(-x41); GNW[42 * 128 + (c - 128)] = (bf16)f2bf(-x42); GNW[43 * 128 + (c - 128)] = (bf16)f2bf(-x43); GNW[44 * 128 + (c - 128)] = (bf16)f2bf(-x44); GNW[45 * 128 + (c - 128)] = (bf16)f2bf(-x45); GNW[46 * 128 + (c - 128)] = (bf16)f2bf(-x46); GNW[47 * 128 + (c - 128)] = (bf16)f2bf(-x47); GNW[48 * 128 + (c - 128)] = (bf16)f2bf(-x48); GNW[49 * 128 + (c - 128)] = (bf16)f2bf(-x49); GNW[50 * 128 + (c - 128)] = (bf16)f2bf(-x50); GNW[51 * 128 + (c - 128)] = (bf16)f2bf(-x51); GNW[52 * 128 + (c - 128)] = (bf16)f2bf(-x52); GNW[53 * 128 + (c - 128)] = (bf16)f2bf(-x53); GNW[54 * 128 + (c - 128)] = (bf16)f2bf(-x54); GNW[55 * 128 + (c - 128)] = (bf16)f2bf(-x55); GNW[56 * 128 + (c - 128)] = (bf16)f2bf(-x56); GNW[57 * 128 + (c - 128)] = (bf16)f2bf(-x57); GNW[58 * 128 + (c - 128)] = (bf16)f2bf(-x58); GNW[59 * 128 + (c - 128)] = (bf16)f2bf(-x59); GNW[60 * 128 + (c - 128)] = (bf16)f2bf(-x60); GNW[61 * 128 + (c - 128)] = (bf16)f2bf(-x61); GNW[62 * 128 + (c - 128)] = (bf16)f2bf(-x62); GNW[63 * 128 + (c - 128)] = (bf16)f2bf(-x63); }
#undef GDN_RHS
#undef GDN_L4
    } else {
        const int t2 = tid - 256; const float gl = gcs[63];
        { const int i = t2 >> 2, d0 = (t2 & 3) * 32; const float e = __expf(gcs[i]);
#pragma unroll
          for (int x8 = 0; x8 < 4; ++x8) { const v4f a = *(const LAS v4f*)(qs + i * QP + d0 + 8 * x8), b = *(const LAS v4f*)(qs + i * QP + d0 + 8 * x8 + 4);
              v4u w; w.x = pk2(a.x * e, a.y * e); w.y = pk2(a.z * e, a.w * e); w.z = pk2(b.x * e, b.y * e); w.w = pk2(b.z * e, b.w * e); *(v4u*)(GQG + i * 128 + d0 + 8 * x8) = w; } }
        { const int d = t2 >> 1, j0 = (t2 & 1) * 32;
#pragma unroll
          for (int x8 = 0; x8 < 4; ++x8) { float o[8];
#pragma unroll
              for (int x = 0; x < 8; ++x) { const int j = j0 + 8 * x8 + x; o[x] = ks[j * QP + d] * __expf(gl - gcs[j]); }
              v4u w; w.x = pk2(o[0], o[1]); w.y = pk2(o[2], o[3]); w.z = pk2(o[4], o[5]); w.w = pk2(o[6], o[7]); *(v4u*)(GKT + d * 64 + j0 + 8 * x8) = w; } }
        if (t2 == 0) GDL[item] = __expf(gl);
    }
    __syncthreads();
}
struct GdnFrags { bf16x8_t nw[4], qg[4], at[2], kt[2][2]; float u[4]; float dl; };
__device__ __forceinline__ void gdn_load(GdnFrags& F, const Params& p, int item, int off128, int off64, int offk, int offu) {
    const bf16* GNW = (const bf16*)(p.ws + WS_GNW) + (size_t)item * 8192; const bf16* GQG = (const bf16*)(p.ws + WS_GQG) + (size_t)item * 8192;
    const bf16* GAT = (const bf16*)(p.ws + WS_GAT) + (size_t)item * 4096; const bf16* GKT = (const bf16*)(p.ws + WS_GKT) + (size_t)item * 8192; const float* GU = (const float*)(p.ws + WS_GU) + (size_t)item * 8192;
#pragma unroll
    for (int ks = 0; ks < 4; ++ks) { F.nw[ks] = *(const bf16x8_t*)(GNW + off128 + 32 * ks); F.qg[ks] = *(const bf16x8_t*)(GQG + off128 + 32 * ks); }
#pragma unroll
    for (int ks = 0; ks < 2; ++ks) { F.at[ks] = *(const bf16x8_t*)(GAT + off64 + 32 * ks); F.kt[0][ks] = *(const bf16x8_t*)(GKT + offk + 32 * ks); F.kt[1][ks] = *(const bf16x8_t*)(GKT + offk + 1024 + 32 * ks); }
#pragma unroll
    for (int r = 0; r < 4; ++r) F.u[r] = GU[offu + r * 128];
    F.dl = ((const float*)(p.ws + WS_GDL))[item];
}
constexpr int STP = 136, VNP = 72;
__device__ __forceinline__ void gdn_seq(const Params& p, LAS unsigned char* lds, int wgi, int wave, int lane) {
    const int u = wgi * 2 + (wave >> 2), wi = wave & 3, h = u >> 3, sl = u & 7, g = lane >> 4, c = lane & 15;
    LAS unsigned short* ST = (LAS unsigned short*)(lds + (wave >> 2) * 12288);
    LAS unsigned short* VNT = ST + 2 * 16 * STP;
    float* GO = (float*)(p.ws + WS_GO);
    const int off128 = (16 * wi + c) * 128 + 8 * g, off64 = (16 * wi + c) * 64 + 8 * g, offk = (32 * wi + c) * 64 + 8 * g, offu = (16 * wi + 4 * g) * 128 + 16 * sl + c;
#pragma unroll
    for (int mt = 0; mt < 2; ++mt) *(LAS v2u*)(ST + c * STP + 16 * (2 * wi + mt) + 4 * g) = (v2u){0u, 0u};
    pg8::f32x4 Sacc[2] = {{0.f, 0.f, 0.f, 0.f}, {0.f, 0.f, 0.f, 0.f}};
    __syncthreads();
    GdnFrags F0, F1;
    gdn_load(F0, p, h, off128, off64, offk, offu);
#define GDN_STEP(F, n_) do { const int cur = (n_) & 1; bf16x8_t sf[4]; \
        _Pragma("unroll") for (int ks = 0; ks < 4; ++ks) sf[ks] = *(const LAS bf16x8_t*)(ST + cur * 16 * STP + c * STP + 32 * ks + 8 * g); \
        pg8::f32x4 vn = {F.u[0], F.u[1], F.u[2], F.u[3]}; \
        _Pragma("unroll") for (int ks = 0; ks < 4; ++ks) vn = __builtin_amdgcn_mfma_f32_16x16x32_bf16(F.nw[ks], sf[ks], vn, 0, 0, 0); \
        { v2u w; w.x = pk2(vn[0], vn[1]); w.y = pk2(vn[2], vn[3]); *(LAS v2u*)(VNT + c * VNP + 16 * wi + 4 * g) = w; } \
        LDS_BAR(); \
        const bf16x8_t v0 = *(const LAS bf16x8_t*)(VNT + c * VNP + 8 * g), v1 = *(const LAS bf16x8_t*)(VNT + c * VNP + 32 + 8 * g); \
        pg8::f32x4 o = {0.f, 0.f, 0.f, 0.f}; \
        _Pragma("unroll") for (int ks = 0; ks < 4; ++ks) o = __builtin_amdgcn_mfma_f32_16x16x32_bf16(F.qg[ks], sf[ks], o, 0, 0, 0); \
        o = __builtin_amdgcn_mfma_f32_16x16x32_bf16(F.at[0], v0, o, 0, 0, 0); o = __builtin_amdgcn_mfma_f32_16x16x32_bf16(F.at[1], v1, o, 0, 0, 0); \
        { const size_t tb = (size_t)(n_) * 64 + 16 * wi + 4 * g; _Pragma("unroll") for (int r = 0; r < 4; ++r) GO[(tb + r) * BW + h * 128 + 16 * sl + c] = o[r]; } \
        _Pragma("unroll") for (int mt = 0; mt < 2; ++mt) { Sacc[mt] = Sacc[mt] * F.dl; \
            Sacc[mt] = __builtin_amdgcn_mfma_f32_16x16x32_bf16(F.kt[mt][0], v0, Sacc[mt], 0, 0, 0); Sacc[mt] = __builtin_amdgcn_mfma_f32_16x16x32_bf16(F.kt[mt][1], v1, Sacc[mt], 0, 0, 0); \
            v2u w; w.x = pk2(Sacc[mt][0], Sacc[mt][1]); w.y = pk2(Sacc[mt][2], Sacc[mt][3]); *(LAS v2u*)(ST + (cur ^ 1) * 16 * STP + c * STP + 16 * (2 * wi + mt) + 4 * g) = w; } \
        LDS_BAR(); } while (0)
    for (int n = 0; n < T / 64; n += 2) {
        gdn_load(F1, p, (n + 1) * 4 + h, off128, off64, offk, offu);
        GDN_STEP(F0, n);
        gdn_load(F0, p, ((n + 2 < T / 64) ? n + 2 : n) * 4 + h, off128, off64, offk, offu);
        GDN_STEP(F1, n + 1);
    }
#undef GDN_STEP
}

constexpr int SEQ_UOFF = 132096;
constexpr int GI_NW = 0, GI_QG = 8704, GI_AT = 17408, GI_KT = 22016, GI_SZ = 31232;
struct GdnStage { v4u r[7]; float u[4]; float dl; };
__device__ __forceinline__ void gdn_stage_load(GdnStage& Sg, const Params& p, int item, int tid, int offu) {
    const bf16* GNW = (const bf16*)(p.ws + WS_GNW) + (size_t)item * 8192; const bf16* GQG = (const bf16*)(p.ws + WS_GQG) + (size_t)item * 8192;
    const bf16* GAT = (const bf16*)(p.ws + WS_GAT) + (size_t)item * 4096; const bf16* GKT = (const bf16*)(p.ws + WS_GKT) + (size_t)item * 8192; const float* GU = (const float*)(p.ws + WS_GU) + (size_t)item * 8192;
    Sg.r[0] = *(const v4u*)(GNW + 8 * tid); Sg.r[1] = *(const v4u*)(GNW + 8 * (tid + 512)); Sg.r[2] = *(const v4u*)(GQG + 8 * tid); Sg.r[3] = *(const v4u*)(GQG + 8 * (tid + 512));
    Sg.r[4] = *(const v4u*)(GAT + 8 * tid); Sg.r[5] = *(const v4u*)(GKT + 8 * tid); Sg.r[6] = *(const v4u*)(GKT + 8 * (tid + 512));
#pragma unroll
    for (int r = 0; r < 4; ++r) Sg.u[r] = GU[offu + r * 128];
    Sg.dl = ((const float*)(p.ws + WS_GDL))[item];
}
__device__ __forceinline__ void gdn_stage_write(const GdnStage& Sg, LAS unsigned short* img, int tid) {
    { const int p0 = tid, p1 = tid + 512;
      *(LAS v4u*)(img + GI_NW + (p0 >> 4) * 136 + 8 * (p0 & 15)) = Sg.r[0]; *(LAS v4u*)(img + GI_NW + (p1 >> 4) * 136 + 8 * (p1 & 15)) = Sg.r[1];
      *(LAS v4u*)(img + GI_QG + (p0 >> 4) * 136 + 8 * (p0 & 15)) = Sg.r[2]; *(LAS v4u*)(img + GI_QG + (p1 >> 4) * 136 + 8 * (p1 & 15)) = Sg.r[3];
      *(LAS v4u*)(img + GI_AT + (p0 >> 3) * 72 + 8 * (p0 & 7)) = Sg.r[4];
      *(LAS v4u*)(img + GI_KT + (p0 >> 3) * 72 + 8 * (p0 & 7)) = Sg.r[5]; *(LAS v4u*)(img + GI_KT + (p1 >> 3) * 72 + 8 * (p1 & 7)) = Sg.r[6]; }
}
__device__ __forceinline__ void gdn_seq2(const Params& p, LAS unsigned char* lds, int wgi, int tid, int wave, int lane) {
    const int h = wgi >> 2, sl = 2 * (wgi & 3) + (wave >> 2), wi = wave & 3, g = lane >> 4, c = lane & 15;
    LAS unsigned short* IMG = (LAS unsigned short*)lds;
    LAS unsigned short* ST = (LAS unsigned short*)(lds + SEQ_UOFF + (wave >> 2) * 12288);
    LAS unsigned short* VNT = ST + 2 * 16 * STP;
    float* GO = (float*)(p.ws + WS_GO);
    const int offu = (16 * wi + 4 * g) * 128 + 16 * sl + c;
#pragma unroll
    for (int mt = 0; mt < 2; ++mt) *(LAS v2u*)(ST + c * STP + 16 * (2 * wi + mt) + 4 * g) = (v2u){0u, 0u};
    pg8::f32x4 Sacc[2] = {{0.f, 0.f, 0.f, 0.f}, {0.f, 0.f, 0.f, 0.f}};
    GdnStage A, B;
    gdn_stage_load(A, p, h, tid, offu); gdn_stage_write(A, IMG, tid);
    gdn_stage_load(B, p, 4 + h, tid, offu);
    LDS_BAR();
    constexpr int NCH = T / 64;
#define GDN_STEP2(X, Y, n_) do { const int cur = (n_) & 1; const LAS unsigned short* im = IMG + cur * GI_SZ; bf16x8_t sf[4]; \
        _Pragma("unroll") for (int ks = 0; ks < 4; ++ks) sf[ks] = *(const LAS bf16x8_t*)(ST + cur * 16 * STP + c * STP + 32 * ks + 8 * g); \
        pg8::f32x4 vn = {X.u[0], X.u[1], X.u[2], X.u[3]}; const float dl = X.dl; \
        _Pragma("unroll") for (int ks = 0; ks < 4; ++ks) vn = __builtin_amdgcn_mfma_f32_16x16x32_bf16(*(const LAS bf16x8_t*)(im + GI_NW + (16 * wi + c) * 136 + 32 * ks + 8 * g), sf[ks], vn, 0, 0, 0); \
        { v2u w; w.x = pk2(vn[0], vn[1]); w.y = pk2(vn[2], vn[3]); *(LAS v2u*)(VNT + c * VNP + 16 * wi + 4 * g) = w; } \
        pg8::f32x4 o = {0.f, 0.f, 0.f, 0.f}; \
        _Pragma("unroll") for (int ks = 0; ks < 4; ++ks) o = __builtin_amdgcn_mfma_f32_16x16x32_bf16(*(const LAS bf16x8_t*)(im + GI_QG + (16 * wi + c) * 136 + 32 * ks + 8 * g), sf[ks], o, 0, 0, 0); \
        LDS_BAR(); \
        gdn_stage_load(X, p, (((n_) + 2 < NCH) ? (n_) + 2 : (n_)) * 4 + h, tid, offu); \
        const bf16x8_t v0 = *(const LAS bf16x8_t*)(VNT + c * VNP + 8 * g), v1 = *(const LAS bf16x8_t*)(VNT + c * VNP + 32 + 8 * g); \
        o = __builtin_amdgcn_mfma_f32_16x16x32_bf16(*(const LAS bf16x8_t*)(im + GI_AT + (16 * wi + c) * 72 + 8 * g), v0, o, 0, 0, 0); \
        o = __builtin_amdgcn_mfma_f32_16x16x32_bf16(*(const LAS bf16x8_t*)(im + GI_AT + (16 * wi + c) * 72 + 32 + 8 * g), v1, o, 0, 0, 0); \
        { const size_t tb = (size_t)(n_) * 64 + 16 * wi + 4 * g; _Pragma("unroll") for (int r = 0; r < 4; ++r) GO[(tb + r) * BW + h * 128 + 16 * sl + c] = o[r]; } \
        _Pragma("unroll") for (int mt = 0; mt < 2; ++mt) { Sacc[mt] = Sacc[mt] * dl; \
            Sacc[mt] = __builtin_amdgcn_mfma_f32_16x16x32_bf16(*(const LAS bf16x8_t*)(im + GI_KT + (16 * (2 * wi + mt) + c) * 72 + 8 * g), v0, Sacc[mt], 0, 0, 0); \
            Sacc[mt] = __builtin_amdgcn_mfma_f32_16x16x32_bf16(*(const LAS bf16x8_t*)(im + GI_KT + (16 * (2 * wi + mt) + c) * 72 + 32 + 8 * g), v1, Sacc[mt], 0, 0, 0); \
            v2u w; w.x = pk2(Sacc[mt][0], Sacc[mt][1]); w.y = pk2(Sacc[mt][2], Sacc[mt][3]); *(LAS v2u*)(ST + (cur ^ 1) * 16 * STP + c * STP + 16 * (2 * wi + mt) + 4 * g) = w; } \
        gdn_stage_write(Y, IMG + (cur ^ 1) * GI_SZ, tid); \
        LDS_BAR(); } while (0)
    for (int n = 0; n < NCH; n += 2) { GDN_STEP2(A, B, n); GDN_STEP2(B, A, n + 1); }
#undef GDN_STEP2
}
constexpr int MI_Q = 0, MI_S = 4608, MI_K = 9216, MI_SZ = 13824;
struct MlStage { v4u r[3]; bf16x8_t vt[2]; float fl; };
__device__ __forceinline__ void ml_stage_load(MlStage& Sg, const Params& p, int item, int tid, int offV) {
    const bf16* MQ = (const bf16*)(p.ws + WS_MQ) + (size_t)item * 4096; const bf16* MS = (const bf16*)(p.ws + WS_MS) + (size_t)item * 4096; const bf16* MK = (const bf16*)(p.ws + WS_MK) + (size_t)item * 4096;
    const bf16* MV = (const bf16*)(p.ws + WS_MV) + (size_t)item * 9216;
    Sg.r[0] = *(const v4u*)(MQ + 8 * tid); Sg.r[1] = *(const v4u*)(MS + 8 * tid); Sg.r[2] = *(const v4u*)(MK + 8 * tid);
    Sg.vt[0] = *(const bf16x8_t*)(MV + offV); Sg.vt[1] = *(const bf16x8_t*)(MV + offV + 32);
    Sg.fl = ((const float*)(p.ws + WS_MFL))[item];
}
__device__ __forceinline__ void ml_stage_write(const MlStage& Sg, LAS unsigned short* img, int tid) {
    const int o = (tid >> 3) * 72 + 8 * (tid & 7);
    *(LAS v4u*)(img + MI_Q + o) = Sg.r[0]; *(LAS v4u*)(img + MI_S + o) = Sg.r[1]; *(LAS v4u*)(img + MI_K + o) = Sg.r[2];
}
__device__ __forceinline__ void ml_seq2(const Params& p, LAS unsigned char* lds, int wgi, int tid, int wave, int lane) {
    const int h = wgi / 5, sl0 = 2 * (wgi % 5) + (wave >> 2), wi = wave & 3, g = lane >> 4, c = lane & 15;
    const bool real = sl0 < 9; const int sl = real ? sl0 : 8;
    LAS unsigned short* IMG = (LAS unsigned short*)lds;
    LAS unsigned short* CT = (LAS unsigned short*)(lds + SEQ_UOFF + (wave >> 2) * 8192);
    float* HO = (float*)(p.ws + WS_HO); float* HDEN = (float*)(p.ws + WS_HDEN);
    const int offV = (16 * sl + c) * 64 + 8 * g;
    *(LAS v2u*)(CT + c * 72 + 16 * wi + 4 * g) = (v2u){0u, 0u};
    pg8::f32x4 Cacc = {0.f, 0.f, 0.f, 0.f};
    MlStage A, B;
    ml_stage_load(A, p, h, tid, offV); ml_stage_write(A, IMG, tid);
    ml_stage_load(B, p, 4 + h, tid, offV);
    LDS_BAR();
    constexpr int NCH = T / 64;
#define ML_STEP2(X, Y, n_) do { const int cur = (n_) & 1; const LAS unsigned short* im = IMG + cur * MI_SZ; const int ro = (16 * wi + c) * 72 + 8 * g; \
        const bf16x8_t c0 = *(const LAS bf16x8_t*)(CT + cur * 16 * 72 + c * 72 + 8 * g), c1 = *(const LAS bf16x8_t*)(CT + cur * 16 * 72 + c * 72 + 32 + 8 * g); \
        const bf16x8_t vt0 = X.vt[0], vt1 = X.vt[1]; const float fl = X.fl; \
        pg8::f32x4 num = {0.f, 0.f, 0.f, 0.f}; \
        num = __builtin_amdgcn_mfma_f32_16x16x32_bf16(*(const LAS bf16x8_t*)(im + MI_Q + ro), c0, num, 0, 0, 0); num = __builtin_amdgcn_mfma_f32_16x16x32_bf16(*(const LAS bf16x8_t*)(im + MI_Q + ro + 32), c1, num, 0, 0, 0); \
        num = __builtin_amdgcn_mfma_f32_16x16x32_bf16(*(const LAS bf16x8_t*)(im + MI_S + ro), vt0, num, 0, 0, 0); num = __builtin_amdgcn_mfma_f32_16x16x32_bf16(*(const LAS bf16x8_t*)(im + MI_S + ro + 32), vt1, num, 0, 0, 0); \
        Cacc = Cacc * fl; \
        Cacc = __builtin_amdgcn_mfma_f32_16x16x32_bf16(*(const LAS bf16x8_t*)(im + MI_K + ro), vt0, Cacc, 0, 0, 0); Cacc = __builtin_amdgcn_mfma_f32_16x16x32_bf16(*(const LAS bf16x8_t*)(im + MI_K + ro + 32), vt1, Cacc, 0, 0, 0); \
        ml_stage_load(X, p, (((n_) + 2 < NCH) ? (n_) + 2 : (n_)) * 4 + h, tid, offV); \
        { v2u w; w.x = pk2(Cacc[0], Cacc[1]); w.y = pk2(Cacc[2], Cacc[3]); *(LAS v2u*)(CT + (cur ^ 1) * 16 * 72 + c * 72 + 16 * wi + 4 * g) = w; } \
        { const size_t tb = (size_t)(n_) * 64 + 16 * wi + 4 * g; \
          if (sl < 8) { _Pragma("unroll") for (int r = 0; r < 4; ++r) HO[(tb + r) * BW + h * 128 + 16 * sl + c] = num[r]; } \
          else if (c == 0 && real) { _Pragma("unroll") for (int r = 0; r < 4; ++r) HDEN[(tb + r) * 4 + h] = num[r]; } } \
        ml_stage_write(Y, IMG + (cur ^ 1) * MI_SZ, tid); \
        LDS_BAR(); } while (0)
    for (int n = 0; n < NCH; n += 2) { ML_STEP2(A, B, n); ML_STEP2(B, A, n + 1); }
#undef ML_STEP2
}

__device__ __forceinline__ void mixer_gmlp_item(const Params& p, int l, LAS unsigned char* lds, int item, int tid, int wave, int lane) {
    const int chunk = item >> 2, g = item & 3; const size_t tok0 = (size_t)chunk * 128;
    const bf16* Z = (const bf16*)(p.ws + WS_Z); bf16* BR1 = (bf16*)(p.ws + WS_BR) + 1 * BW;
    const float* ng = p.in[I_GMNG] + l * BW; const float* nb = p.in[I_GMNB] + l * BW;
    const float* wsp = p.in[I_GMWS] + ((size_t)(l * 4 + g) * 128) * 128; const float* bsp = p.in[I_GMBS] + (l * 4 + g) * 128;
    LAS float* vn = (LAS float*)lds;
    for (int r = 0; r < 16; ++r) { const int tk = wave * 16 + r;
        const v4u raw = *(const v4u*)(Z + (tok0 + tk) * ZC + ZC_GMV + 8 * lane); float x[8]; unpack8(raw, x); float s = 0.f;
#pragma unroll
        for (int i = 0; i < 8; ++i) { x[i] = gelu_tanh(x[i]); s += x[i]; }
        const float mean = wave_sum(s) * (1.f / 512.f); float ss = 0.f;
#pragma unroll
        for (int i = 0; i < 8; ++i) { x[i] -= mean; ss += x[i] * x[i]; }
        const float rstd = rsqrtf(wave_sum(ss) * (1.f / 512.f) + LN_EPS);
        if ((lane >> 4) == g) { const int cl = 8 * (lane & 15);
#pragma unroll
            for (int i = 0; i < 8; ++i) vn[tk * 128 + cl + i] = x[i] * rstd * ng[8 * lane + i] + nb[8 * lane + i]; }
    }
    __syncthreads();
    const int t = tid >> 2, cq = tid & 3; float acc[32];
#pragma unroll
    for (int i = 0; i < 32; ++i) acc[i] = 0.f;
    const float* wrow = wsp + (size_t)t * 128;
    for (int s = 0; s <= t; ++s) { const float w = wrow[s]; const LAS float* row = vn + s * 128 + cq * 32;
#pragma unroll
        for (int i4 = 0; i4 < 8; ++i4) { const v4f a = *(const LAS v4f*)(row + 4 * i4); acc[4 * i4] += w * a.x; acc[4 * i4 + 1] += w * a.y; acc[4 * i4 + 2] += w * a.z; acc[4 * i4 + 3] += w * a.w; } }
    const float bias = bsp[t];
#pragma unroll
    for (int i8 = 0; i8 < 4; ++i8) { const v4u raw = *(const v4u*)(Z + (tok0 + t) * ZC + ZC_GMU + g * 128 + cq * 32 + 8 * i8); float u[8]; unpack8(raw, u); float o[8];
#pragma unroll
        for (int i = 0; i < 8; ++i) o[i] = gelu_tanh(u[i]) * (acc[8 * i8 + i] + bias);
#if MERGE_FP8
        *(v2u*)((unsigned char*)(p.ws + WS_BR) + (tok0 + t) * BRW + 1 * BW + g * 128 + cq * 32 + 8 * i8) = (v2u){pk4_f8(o[0], o[1], o[2], o[3], BRSC), pk4_f8(o[4], o[5], o[6], o[7], BRSC)}; }
#else
        v4u w; w.x = pk2(o[0], o[1]); w.y = pk2(o[2], o[3]); w.z = pk2(o[4], o[5]); w.w = pk2(o[6], o[7]);
        *(v4u*)(BR1 + (tok0 + t) * BRW + g * 128 + cq * 32 + 8 * i8) = w; }
#endif
    __syncthreads();
}

__device__ __forceinline__ void vt_item(const Params& p, LAS unsigned char* lds, int item, int tid) {
    const int h = item & 3, n = item >> 2; const size_t t0 = (size_t)n * 64;
    const bf16* Z = (const bf16*)(p.ws + WS_Z); bf16* VT = (bf16*)(p.ws + WS_VT);
    LAS unsigned short* vs = (LAS unsigned short*)lds;
#pragma unroll
    for (int r = 0; r < 2; ++r) { const int idx = tid + 512 * r, tk = idx >> 4, c8 = idx & 15;
        *(LAS v4u*)(vs + tk * 136 + 8 * c8) = *(const v4u*)(Z + (t0 + tk) * ZC + ZC_SBV + h * 128 + 8 * c8); }
    __syncthreads();
    { const int d = tid >> 2, jq = tid & 3; unsigned w[8];
#pragma unroll
      for (int x = 0; x < 8; ++x) w[x] = (unsigned)vs[(16 * jq + 2 * x) * 136 + d] | ((unsigned)vs[(16 * jq + 2 * x + 1) * 136 + d] << 16);
      bf16* dst = VT + ((size_t)h * 128 + d) * T + t0 + 16 * jq;
      *(v4u*)dst = (v4u){w[0], w[1], w[2], w[3]}; *(v4u*)(dst + 8) = (v4u){w[4], w[5], w[6], w[7]}; }
    __syncthreads();
}
constexpr int KTP = 136, VTP = 72;
__device__ __forceinline__ void sb_unit(const Params& p, LAS unsigned char* lds, int unit, int tid, int wave, int lane) {
    const int h = unit >> 6, q0 = (unit & 63) * 128, g = lane >> 4, c = lane & 15; const int qrow = q0 + 16 * wave + c;
    const bf16* Z = (const bf16*)(p.ws + WS_Z); const bf16* VT = (const bf16*)(p.ws + WS_VT) + (size_t)h * 128 * T; bf16* BR0 = (bf16*)(p.ws + WS_BR);
    LAS unsigned short* Kt = (LAS unsigned short*)lds;
    LAS unsigned short* Vt = Kt + 2 * 64 * KTP;
    LAS int* flags = (LAS int*)(Vt + 2 * 128 * VTP);
    bf16x8_t qf[4];
#pragma unroll
    for (int ks = 0; ks < 4; ++ks) qf[ks] = *(const bf16x8_t*)(Z + (size_t)qrow * ZC + ZC_SBQ + h * 128 + 32 * ks + 8 * g);
    pg8::f32x4 acc[8];
#pragma unroll
    for (int dt = 0; dt < 8; ++dt) acc[dt] = (pg8::f32x4){0.f, 0.f, 0.f, 0.f};
    float racc = 0.f;
    v4u kr[2], vr[2];
    const int jt = (q0 >> 6) + 1;
#define SB_GLOAD(j_) do { _Pragma("unroll") for (int r = 0; r < 2; ++r) { const int idx = tid + 512 * r; \
        kr[r] = *(const v4u*)(Z + (size_t)(64 * (j_) + (idx >> 4)) * ZC + ZC_SBK + h * 128 + 8 * (idx & 15)); \
        vr[r] = *(const v4u*)(VT + (size_t)(idx >> 3) * T + 64 * (j_) + 8 * (idx & 7)); } } while (0)
#define SB_LWRITE(b_) do { _Pragma("unroll") for (int r = 0; r < 2; ++r) { const int idx = tid + 512 * r; \
        *(LAS v4u*)(Kt + (b_) * 64 * KTP + (idx >> 4) * KTP + 8 * (idx & 15)) = kr[r]; *(LAS v4u*)(Vt + (b_) * 128 * VTP + (idx >> 3) * VTP + 8 * (idx & 7)) = vr[r]; } } while (0)
    LDS_BAR();
    SB_GLOAD(jt); SB_LWRITE(0);
    LDS_BAR();
    for (int j = jt, it = 0; j >= 0; --j, ++it) {
        const int cur = it & 1;
        SB_GLOAD(j > 0 ? j - 1 : 0);
        const bool wdone = __all(racc > 104.f);
        if (64 * j < q0 + 16 * wave + 15 && !wdone) {
            const LAS unsigned short* Kc = Kt + cur * 64 * KTP; const LAS unsigned short* Vc = Vt + cur * 128 * VTP;
            pg8::f32x4 z[4];
#pragma unroll
            for (int s = 0; s < 4; ++s) { z[s] = (pg8::f32x4){0.f, 0.f, 0.f, 0.f};
#pragma unroll
                for (int ks = 0; ks < 4; ++ks) z[s] = __builtin_amdgcn_mfma_f32_16x16x32_bf16(*(const LAS bf16x8_t*)(Kc + (16 * s + c) * KTP + 32 * ks + 8 * g), qf[ks], z[s], 0, 0, 0); }
            float sp[4][4], t[4], xs[4]; bool mk[4][4];
#pragma unroll
            for (int s = 0; s < 4; ++s) { t[s] = 0.f;
#pragma unroll
                for (int r = 0; r < 4; ++r) { const int key = 64 * j + 16 * s + 4 * g + r; mk[s][r] = key < qrow; const float zz = z[s][r] * 0.08838834764831845f; z[s][r] = zz;
                    sp[s][r] = mk[s][r] ? softplusf_(zz) : 0.f; t[s] += sp[s][r]; } }
            float grand = 0.f, higher[4];
#pragma unroll
            for (int s = 3; s >= 0; --s) { float x = t[s]; float y = __shfl(x, lane + 16); x += (g < 3) ? y : 0.f; y = __shfl(x, lane + 32); x += (g < 2) ? y : 0.f;
                xs[s] = x - t[s];
                const float tot = __shfl(x, c); higher[s] = grand; grand += tot; }
            bf16x8_t pf[2];
#pragma unroll
            for (int s = 0; s < 4; ++s) { float a[4]; float e = 0.f;
#pragma unroll
                for (int r = 3; r >= 0; --r) { const float la = z[s][r] - sp[s][r] - (racc + higher[s] + xs[s] + e); a[r] = mk[s][r] ? __expf(la) : 0.f; e += sp[s][r]; }
                const unsigned w0 = pk2(a[0], a[1]), w1 = pk2(a[2], a[3]);
                if ((s & 1) == 0) { pf[s >> 1][0] = (short)(w0 & 0xffff); pf[s >> 1][1] = (short)(w0 >> 16); pf[s >> 1][2] = (short)(w1 & 0xffff); pf[s >> 1][3] = (short)(w1 >> 16); }
                else              { pf[s >> 1][4] = (short)(w0 & 0xffff); pf[s >> 1][5] = (short)(w0 >> 16); pf[s >> 1][6] = (short)(w1 & 0xffff); pf[s >> 1][7] = (short)(w1 >> 16); } }
            racc += grand;
#pragma unroll
            for (int dt = 0; dt < 8; ++dt)
#pragma unroll
                for (int k2 = 0; k2 < 2; ++k2) { const v2u lo = *(const LAS v2u*)(Vc + (16 * dt + c) * VTP + 32 * k2 + 4 * g), hi = *(const LAS v2u*)(Vc + (16 * dt + c) * VTP + 32 * k2 + 16 + 4 * g);
                    const v4u vv = (v4u){lo.x, lo.y, hi.x, hi.y};
                    acc[dt] = __builtin_amdgcn_mfma_f32_16x16x32_bf16(__builtin_bit_cast(bf16x8_t, vv), pf[k2], acc[dt], 0, 0, 0); }
        }
        const bool wd2 = __all(racc > 104.f);
        if (lane == 0) flags[cur * 8 + wave] = wd2 ? 1 : 0;
        SB_LWRITE(cur ^ 1);
        LDS_BAR();
        int alld = 1;
#pragma unroll
        for (int w = 0; w < 8; ++w) alld &= flags[cur * 8 + w];
        if (alld) break;
    }
#undef SB_GLOAD
#undef SB_LWRITE
#pragma unroll
#if MERGE_FP8
    for (int dt = 0; dt < 8; ++dt) *(unsigned*)((unsigned char*)BR0 + (size_t)qrow * BRW + h * 128 + 16 * dt + 4 * g) = pk4_f8(acc[dt][0], acc[dt][1], acc[dt][2], acc[dt][3], BRSC);
#else
    for (int dt = 0; dt < 8; ++dt) { v2u w; w.x = pk2(acc[dt][0], acc[dt][1]); w.y = pk2(acc[dt][2], acc[dt][3]); *(v2u*)(BR0 + (size_t)qrow * BRW + h * 128 + 16 * dt + 4 * g) = w; }
#endif
}

__device__ __forceinline__ void phase_mixers(const Params& p, int l, LAS unsigned char* lds, int wg, int G, int tid, int wave, int lane, const XcdBarrier& bar) {
#if defined(PROBE_SPLIT)
    if (wg < 16) gdn_seq2(p, lds, wg, tid, wave, lane); else if (wg < 36) ml_seq2(p, lds, wg - 16, tid, wave, lane);
    xcd_barrier(bar);
    const int w2 = wg, G2 = G;
#else
    if (wg < 16) { gdn_seq2(p, lds, wg, tid, wave, lane); return; }
    if (wg < 36) { ml_seq2(p, lds, wg - 16, tid, wave, lane); return; }
    const int w2 = wg - 36, G2 = G - 36;
#endif
    for (int it = w2; it < 256; it += G2) mixer_gmlp_item(p, l, lds, it, tid, wave, lane);
    for (int it = w2; it < 256; it += G2) sb_unit(p, lds, it, tid, wave, lane);
#if !defined(PROBE_CONV0)
    __syncthreads();
    {
        constexpr int NIT1 = (NEX * 2 * (D / 64) * (ED / 32)) + (NEX * (ED / 64) * (D / 32));
        const int nheavy = (G2 < 256 && 2 * G2 >= 256) ? 256 - G2 : 0, per_wave = NIT1 / (G2 * 8);
        const int NA = (nheavy > 0 && per_wave > 2 * CONV_SKIP) ? (per_wave - CONV_SKIP) * (G2 * 8) : NIT1;
        phase_convert<1>(p, l, lds, w2 * 8 + wave, G2 * 8, wave, lane, false, 0, NA);
        if (NA < NIT1 && w2 >= nheavy) phase_convert<1>(p, l, lds, (w2 - nheavy) * 8 + wave, (G2 - nheavy) * 8, wave, lane, false, NA, NIT1); }
#endif
}

__device__ __forceinline__ void phase_post(const Params& p, int l, int gw, int NGW, int lane) {
    const bf16* Z = (const bf16*)(p.ws + WS_Z); const float* GO = (const float*)(p.ws + WS_GO); const float* HO = (const float*)(p.ws + WS_HO); const float* HDEN = (const float*)(p.ws + WS_HDEN);
    bf16* BR2 = (bf16*)(p.ws + WS_BR) + 2 * BW; bf16* BR3 = (bf16*)(p.ws + WS_BR) + 3 * BW;
    const float* gng = p.in[I_GDNNG] + l * 128; const float* mng = p.in[I_MLNG] + l * BW;
    for (int t = gw; t < T; t += NGW) {
        {   const v4f a0 = *(const v4f*)(GO + (size_t)t * BW + 8 * lane), a1 = *(const v4f*)(GO + (size_t)t * BW + 8 * lane + 4); float o[8] = {a0.x, a0.y, a0.z, a0.w, a1.x, a1.y, a1.z, a1.w}; float ss = 0.f;
#pragma unroll
            for (int i = 0; i < 8; ++i) ss += o[i] * o[i];
            const float r = rsqrtf(sum16(ss) * (1.f / 128.f) + LN_EPS);
            const v4u graw = *(const v4u*)(Z + (size_t)t * ZC + ZC_GDNG + 8 * lane); float gt[8]; unpack8(graw, gt);
#pragma unroll
            for (int i = 0; i < 8; ++i) o[i] = o[i] * r * gng[(8 * lane + i) & 127] * siluf_(gt[i]);
#if MERGE_FP8
            *(v2u*)((unsigned char*)(p.ws + WS_BR) + (size_t)t * BRW + 2 * BW + 8 * lane) = (v2u){pk4_f8(o[0], o[1], o[2], o[3], BRSC), pk4_f8(o[4], o[5], o[6], o[7], BRSC)}; }
#else
            v4u w; w.x = pk2(o[0], o[1]); w.y = pk2(o[2], o[3]); w.z = pk2(o[4], o[5]); w.w = pk2(o[6], o[7]); *(v4u*)(BR2 + (size_t)t * BRW + 8 * lane) = w; }
#endif
        {   const v4f a0 = *(const v4f*)(HO + (size_t)t * BW + 8 * lane), a1 = *(const v4f*)(HO + (size_t)t * BW + 8 * lane + 4); float o[8] = {a0.x, a0.y, a0.z, a0.w, a1.x, a1.y, a1.z, a1.w}; float ss = 0.f;
            const float dn = 1.f / fmaxf(fabsf(HDEN[(size_t)t * 4 + (lane >> 4)]), 1.f);
#pragma unroll
            for (int i = 0; i < 8; ++i) { o[i] *= dn; ss += o[i] * o[i]; }
            const float r = rsqrtf(sum16(ss) * (1.f / 128.f) + LN_EPS);
            const v4u graw = *(const v4u*)(Z + (size_t)t * ZC + ZC_MLO + 8 * lane); float gt[8]; unpack8(graw, gt);
#pragma unroll
            for (int i = 0; i < 8; ++i) o[i] = o[i] * r * mng[8 * lane + i] * sigmoidf_(gt[i]);
#if MERGE_FP8
            *(v2u*)((unsigned char*)(p.ws + WS_BR) + (size_t)t * BRW + 3 * BW + 8 * lane) = (v2u){pk4_f8(o[0], o[1], o[2], o[3], BRSC), pk4_f8(o[4], o[5], o[6], o[7], BRSC)}; }
#else
            v4u w; w.x = pk2(o[0], o[1]); w.y = pk2(o[2], o[3]); w.z = pk2(o[4], o[5]); w.w = pk2(o[6], o[7]); *(v4u*)(BR3 + (size_t)t * BRW + 8 * lane) = w; }
#endif
    }
}

__device__ __forceinline__ void ln_row(const float* yrow, const float* g, const float* b, int lane, v4f (&v)[8]) {
    const v4f* yr = (const v4f*)yrow + lane; float s = 0.f;
#pragma unroll
    for (int j = 0; j < 8; ++j) { v[j] = yr[64 * j]; s += (v[j].x + v[j].y) + (v[j].z + v[j].w); }
    const float mean = wave_sum(s) * (1.f / D); float s2 = 0.f;
#pragma unroll
    for (int j = 0; j < 8; ++j) { v[j] = v[j] - mean; s2 += (v[j].x * v[j].x + v[j].y * v[j].y) + (v[j].z * v[j].z + v[j].w * v[j].w); }
    const float rstd = rsqrtf(wave_sum(s2) * (1.f / D) + LN_EPS);
#pragma unroll
    for (int j = 0; j < 8; ++j) { const v4f gg = ((const v4f*)g)[lane + 64 * j], bb = ((const v4f*)b)[lane + 64 * j]; v[j] = v[j] * rstd * gg + bb; }
}
constexpr int RT_XP = 2052;
constexpr int RT_TAB = 131072 + 1024;
__device__ __forceinline__ void phase_ln1_router(const Params& p, int l, LAS unsigned char* lds, int wg, int G, int wave, int lane, int cnt_shift = 0) {
    const bf16* Y = (const bf16*)(p.ws + WS_Y); bf16* X1 = (bf16*)(p.ws + WS_X1); bf16* X1B = (bf16*)(p.ws + WS_X1B); int* LIST = (int*)(p.ws + WS_LIST); float* WL = (float*)(p.ws + WS_WL); unsigned* SLOT = (unsigned*)(p.ws + WS_SLOT);
    unsigned* cnt = (unsigned*)(p.ws + WS_CTL) + CW_CNT + l * 4096 + cnt_shift;
    const float* g1 = p.in[I_LN1G] + (size_t)l * D; const float* b1 = p.in[I_LN1B] + (size_t)l * D;
    const float* wr = p.in[I_WR] + (size_t)l * D * NE; const float rbias = p.in[I_RB][l * NE + lane];
    LAS float* xt = (LAS float*)lds;
    LAS float* part = (LAS float*)lds;
    LAS unsigned char* selm = lds + RT_TAB; LAS unsigned char* rkm = selm + 4096; LAS float* wtm = (LAS float*)(rkm + 4096); LAS unsigned* basem = (LAS unsigned*)(wtm + 4096);
    const int n_l = lane & 15, kq = lane >> 4;
    int gi = 0;
    for (int tg = wg; tg < T / 16; tg += G, ++gi) {
        {   v4f va[8], vb[8]; const size_t m0 = (size_t)tg * 16 + 2 * wave;
#pragma unroll
            for (int j = 0; j < 8; ++j) { va[j] = ld4(Y, m0 * D + 4 * lane + 256 * j, true); vb[j] = ld4(Y, (m0 + 1) * D + 4 * lane + 256 * j, true); }
            float sa = 0.f, sb = 0.f;
#pragma unroll
            for (int j = 0; j < 8; ++j) { sa += (va[j].x + va[j].y) + (va[j].z + va[j].w); sb += (vb[j].x + vb[j].y) + (vb[j].z + vb[j].w); }
            const float ma = wave_sum(sa) * (1.f / D), mb = wave_sum(sb) * (1.f / D); float qa = 0.f, qb = 0.f;
#pragma unroll
            for (int j = 0; j < 8; ++j) { va[j] = va[j] - ma; vb[j] = vb[j] - mb; qa += (va[j].x * va[j].x + va[j].y * va[j].y) + (va[j].z * va[j].z + va[j].w * va[j].w); qb += (vb[j].x * vb[j].x + vb[j].y * vb[j].y) + (vb[j].z * vb[j].z + vb[j].w * vb[j].w); }
            const float ra = rsqrtf(wave_sum(qa) * (1.f / D) + LN_EPS), rb = rsqrtf(wave_sum(qb) * (1.f / D) + LN_EPS);
#pragma unroll
            for (int j = 0; j < 8; ++j) { const v4f gg = ((const v4f*)g1)[lane + 64 * j], bb = ((const v4f*)b1)[lane + 64 * j]; va[j] = va[j] * ra * gg + bb; vb[j] = vb[j] * rb * gg + bb; }
#pragma unroll
            for (int rr = 0; rr < 2; ++rr) { const size_t m = m0 + rr; v2u* xo = (v2u*)(X1 + m * D) + lane;
#pragma unroll
                for (int j = 0; j < 8; ++j) { const v4f v = rr ? vb[j] : va[j]; xo[64 * j] = (v2u){pk2(v.x, v.y), pk2(v.z, v.w)};
#if MOE_UP_FP8
                    { unsigned w = 0; w = __builtin_amdgcn_cvt_pk_fp8_f32(v.x, v.y, w, false); w = __builtin_amdgcn_cvt_pk_fp8_f32(v.z, v.w, w, true); ((unsigned*)((unsigned char*)X1B + m * D))[lane + 64 * j] = w; }
#else
                    { v2u o; o.x = pk2(v.x, v.y); o.y = pk2(v.z, v.w); ((v2u*)(X1B + m * D))[lane + 64 * j] = o; }
#endif
                    *(LAS v4f*)(xt + (2 * wave + rr) * RT_XP + 4 * lane + 256 * j) = v; } } }
        __syncthreads();
        {   pg8::f32x4 acc[4];
#pragma unroll
            for (int i = 0; i < 4; ++i) acc[i] = (pg8::f32x4){0.f, 0.f, 0.f, 0.f};
            const float* wb = wr + (size_t)(256 * wave + 4 * kq) * NE + 4 * n_l;
            const LAS float* xa = xt + n_l * RT_XP + 256 * wave + 4 * kq;
            v4f bwa[16], bwb[16];
#define RT_LOADW(dst, sb_) do { _Pragma("unroll") for (int q = 0; q < 16; ++q) dst[q] = *(const v4f*)(wb + (size_t)(16 * (4 * (sb_) + (q >> 2)) + (q & 3)) * NE); } while (0)
#define RT_MMA(src, sb_) do { _Pragma("unroll") for (int sg = 0; sg < 4; ++sg) { const v4f a4 = *(const LAS v4f*)(xa + 16 * (4 * (sb_) + sg)); \
                _Pragma("unroll") for (int c = 0; c < 4; ++c) { const v4f b4 = src[sg * 4 + c]; const float a = c == 0 ? a4.x : c == 1 ? a4.y : c == 2 ? a4.z : a4.w; \
                    acc[0] = __builtin_amdgcn_mfma_f32_16x16x4f32(a, b4.x, acc[0], 0, 0, 0); acc[1] = __builtin_amdgcn_mfma_f32_16x16x4f32(a, b4.y, acc[1], 0, 0, 0); \
                    acc[2] = __builtin_amdgcn_mfma_f32_16x16x4f32(a, b4.z, acc[2], 0, 0, 0); acc[3] = __builtin_amdgcn_mfma_f32_16x16x4f32(a, b4.w, acc[3], 0, 0, 0); } } } while (0)
            RT_LOADW(bwa, 0);
#pragma unroll 1
            for (int h = 0; h < 2; ++h) {
                RT_LOADW(bwb, 1); RT_MMA(bwa, 0);
                if (h == 0) RT_LOADW(bwa, 2);
                RT_MMA(bwb, 1);
                wb += (size_t)128 * NE; xa += 128; asm volatile("" : "+v"(wb));
            }
#undef RT_LOADW
#undef RT_MMA
            __syncthreads();
#pragma unroll
            for (int j = 0; j < 4; ++j) *(LAS v4f*)(part + (wave * 16 + 4 * kq + j) * 64 + 4 * n_l) = (v4f){acc[0][j], acc[1][j], acc[2][j], acc[3][j]}; }
        __syncthreads();
#pragma unroll 1
        for (int rr = 0; rr < 2; ++rr) { const int lr = wave + 8 * rr; float logit = 0.f;
#pragma unroll
            for (int w = 0; w < 8; ++w) logit += part[(w * 16 + lr) * 64 + lane];
            const float s = sigmoidf_(logit), biased = s + rbias;
            const float m1 = max8(biased); const float li = (float)(lane & 7);
            const float first = min8(biased == m1 ? li : 8.f);
            const float m2 = max8(li == first ? -INFINITY : biased);
            const float gs = m1 + m2; const int myg = lane >> 3; int grank = 0;
#pragma unroll
            for (int g2 = 0; g2 < 8; ++g2) { const float o = __builtin_bit_cast(float, __builtin_amdgcn_readlane(__builtin_bit_cast(int, gs), g2 * 8)); grank += (o > gs || (o == gs && g2 < myg)) ? 1 : 0; }
            const float masked = grank < 4 ? biased : -INFINITY; int rank = 0;
#pragma unroll
            for (int e2 = 0; e2 < 64; ++e2) { const float o = __builtin_bit_cast(float, __builtin_amdgcn_readlane(__builtin_bit_cast(int, masked), e2)); rank += (o > masked || (o == masked && e2 < lane)) ? 1 : 0; }
            const float wsel = rank < 6 ? s : 0.f; const float tot = wave_sum(wsel);
            const int ri = gi * 16 + lr;
            selm[ri * 64 + lane] = (rank < 6) ? 1 : 0; rkm[ri * 64 + lane] = (unsigned char)rank; wtm[ri * 64 + lane] = wsel / tot * 2.5f; }
        __syncthreads();
    }
    const int nrows = gi * 16;
    if (wave == 0) { unsigned n = 0;
        for (int r = 0; r < nrows; ++r) n += selm[r * 64 + lane];
        unsigned base = 0; if (n && !(PROBE_NOATOM && cnt_shift)) base = __hip_atomic_fetch_add(cnt + 64 * lane, n, __ATOMIC_RELAXED, __HIP_MEMORY_SCOPE_AGENT);
        basem[lane] = base; }
    __syncthreads();
    for (int ri = wave; ri < nrows; ri += 8) { unsigned pos = basem[lane];
        for (int r = 0; r < ri; ++r) pos += selm[r * 64 + lane];
        if (selm[ri * 64 + lane]) { const size_t m = (size_t)(wg + (ri >> 4) * G) * 16 + (ri & 15); const int rk = rkm[ri * 64 + lane];
            LIST[lane * T + pos] = (int)m; WL[lane * T + pos] = wtm[ri * 64 + lane]; SLOT[m * 8 + rk] = ((unsigned)lane << 16) | pos; } }
    __syncthreads();
}
__device__ __forceinline__ void phase_combine_ln2(const Params& p, int l, void* dst, bool dbf, int gw, int NGW, int lane) {
    const bf16* X1 = (const bf16*)(p.ws + WS_X1); const bf16* YE = (const bf16*)(p.ws + WS_YEXP); const unsigned* SLOT = (const unsigned*)(p.ws + WS_SLOT);
    const unsigned* cnt = (const unsigned*)(p.ws + WS_CTL) + CW_CNT + l * 4096;
    const float* g2 = p.in[I_LN2G] + (size_t)l * D; const float* b2 = p.in[I_LN2B] + (size_t)l * D;
    const int tiles = ((int)cnt[64 * lane] + 255) >> 8; const float incl = wave_scan_incl((float)tiles);
    const int toff = (int)incl - tiles;
    const int tsh = __builtin_amdgcn_readlane((int)incl, 63);
    for (int m = gw; m < T; m += NGW) {
        v4f v[8];
#pragma unroll
        for (int j = 0; j < 8; ++j) v[j] = ld4(X1, (size_t)m * D + 4 * lane + 256 * j, true) * ALPHA;
#pragma unroll
        for (int k = 0; k < 7; ++k) { size_t row;
            if (k == 0) row = (size_t)tsh * 256 + m;
            else { const unsigned s = __builtin_amdgcn_readfirstlane(SLOT[(size_t)m * 8 + (k - 1)]); const int e = (int)(s >> 16); row = (size_t)__builtin_amdgcn_readlane(toff, e) * 256 + (s & 0xffffu); }
            const v2u* yr = (const v2u*)(YE + row * D) + lane;
#pragma unroll
            for (int j = 0; j < 8; ++j) { const v2u y = yr[64 * j]; v[j].x += bflo(y.x); v[j].y += bfhi(y.x); v[j].z += bflo(y.y); v[j].w += bfhi(y.y); } }
        float s = 0.f;
#pragma unroll
        for (int j = 0; j < 8; ++j) s += (v[j].x + v[j].y) + (v[j].z + v[j].w);
        const float mean = wave_sum(s) * (1.f / D); float s2 = 0.f;
#pragma unroll
        for (int j = 0; j < 8; ++j) { v[j] = v[j] - mean; s2 += (v[j].x * v[j].x + v[j].y * v[j].y) + (v[j].z * v[j].z + v[j].w * v[j].w); }
        const float rstd = rsqrtf(wave_sum(s2) * (1.f / D) + LN_EPS);
#pragma unroll
        for (int j = 0; j < 8; ++j) { const v4f gg = ((const v4f*)g2)[lane + 64 * j], bb = ((const v4f*)b2)[lane + 64 * j]; const v4f o = v[j] * rstd * gg + bb;
            if (dbf) ((v2u*)((bf16*)dst + (size_t)m * D))[lane + 64 * j] = (v2u){pk2(o.x, o.y), pk2(o.z, o.w)};
            else ((v4f*)((float*)dst + (size_t)m * D))[lane + 64 * j] = o; }
    }
}

constexpr int NPH = 11;
template <class S> struct DupOrder {
    S s; int n;
    __device__ __forceinline__ bool next(int i, Unit& u) const { return s.next(i >= n ? i - n : i, u); }
    __device__ __forceinline__ int row_token(int i, int r) const { return s.row_token(i >= n ? i - n : i, r); }
    __device__ __forceinline__ void a_ready(const Unit& u) const { s.a_ready(u); }
    __device__ __forceinline__ void done(const Unit& u) const { s.done(u); }
};
template <class S> __device__ __forceinline__ int count_units(const S& s) { Unit u; int n = 0; while (n < 64 && s.next(n, u)) ++n; return n; }
#define ORDER_T(k, T) typename std::conditional<PROBE_DUP == (k), DupOrder<T>, T>::type
template <class S> __device__ __forceinline__ DupOrder<S> make_order(const S& s, std::true_type) { DupOrder<S> d{s, count_units(s)}; d.n = count_units(s); return d; }
template <class S> __device__ __forceinline__ S make_order(const S& s, std::false_type) { return s; }
#define MAKE_ORDER(k, s) make_order(s, std::integral_constant<bool, PROBE_DUP == (k)>())
template <int l>
__device__ __forceinline__ void run_layer(const Params& p, LAS unsigned char* lds, const XcdBarrier& bar, int tid, int lane, int wave, int G, int wg, int gw, int NGW) {
    unsigned char* ws = p.ws;
    {
        const void* xin = (l == 0) ? (const void*)p.in[I_X] : (const void*)(ws + WS_XCUR);
        void* xout = (l == NL - 1) ? (void*)p.out : (void*)(ws + WS_XCUR);
#ifndef PROBE_DUP
#define PROBE_DUP (-1)
#endif
#define IS_GEMM_PH(k) ((k) == 1 || (k) == 5 || (k) == 6 || (k) == 8 || (k) == 9)
#define REP(k) _Pragma("nounroll") for (int _r = 0; _r < ((PROBE_DUP == (k) && !IS_GEMM_PH(k)) ? 2 + (p.ph_lo >> 20) : 1); ++_r)
#ifndef PH_MASK
#define PH_MASK 0x7ff
#endif
#define RUN(k) (((PH_MASK >> (k)) & 1) && p.ph_lo <= l * NPH + (k) && l * NPH + (k) < p.ph_hi)
#define SEAM(k) do { if (l * NPH + (k) + 1 < p.ph_hi) xcd_barrier(bar); } while (0)
        if (RUN(0)) { REP(0) { phase_convert<0>(p, l, lds, gw, NGW, wave, lane);
#if defined(PROBE_CONV0)
            phase_convert<1>(p, l, lds, gw, NGW, wave, lane);
#endif
 phase_xprep(p, l, xin, l > 0, lds, gw, NGW, tid, lane); } SEAM(0); }
        if (RUN(1)) { REP(1) { pg8::Gemm g{(const bf16*)(ws + WS_XB), (const bf16*)(ws + WS_WIN), T, ZC, D / 2, D / 2, D / 2}; pg8::StaticOrder S; S.init(T, ZC, G, wg);
            pg8::EpiBf16<0> E{(bf16*)(ws + WS_Z), ZC, nullptr, 0, 0, 1.f / 64.f};
            auto S2 = MAKE_ORDER(1, S); pg8::gemm_phase<pg8::EpiBf16<0>, ORDER_T(1, pg8::StaticOrder), true, true, true>(lds, g, S2, E); } SEAM(1); }
        if (RUN(2)) { REP(2) { for (int it = wg; it < 1536; it += G) { if (it < 512) gdn_pre_item(p, l, lds, it, tid, wave, lane); else if (it < 1024) ml_pre_item(p, l, lds, it - 512, tid, wave, lane); else vt_item(p, lds, it - 1024, tid); } } SEAM(2); }
        if (RUN(3)) { REP(3) { phase_mixers(p, l, lds, wg, G, tid, wave, lane, bar); } SEAM(3); }
        if (RUN(4)) { REP(4) { phase_post(p, l, gw, NGW, lane); } SEAM(4); }
        if (RUN(5)) { REP(5) { constexpr int KM = MERGE_FP8 ? BRW / 2 : BRW; pg8::Gemm g{(const bf16*)(ws + WS_BR), (const bf16*)(ws + WS_WBR), T, D, KM, KM, KM}; pg8::StaticOrder S; S.init(T, D, G, wg);
            EpiMergeH E{(const bf16*)(ws + WS_Z), (bf16*)(ws + WS_MSUM)};
            auto S2 = MAKE_ORDER(5, S); pg8::gemm_phase<EpiMergeH, ORDER_T(5, pg8::StaticOrder), true, true, MERGE_FP8 != 0>(lds, g, S2, E); } SEAM(5); }
        if (RUN(6)) { REP(6) { pg8::Gemm g{(const bf16*)(ws + WS_MSUM), (const bf16*)(ws + WS_WOUT), T, D, D / 2, D / 2, D / 2}; pg8::StaticOrder S; S.init(T, D, G, wg);
            EpiResid E{xin, (bf16*)(ws + WS_Y), 1.f / 64.f, l > 0};
            auto S2 = MAKE_ORDER(6, S); pg8::gemm_phase<EpiResid, ORDER_T(6, pg8::StaticOrder), true, true, true>(lds, g, S2, E); } SEAM(6); }
        if (RUN(7)) { REP(7) { phase_ln1_router(p, l, lds, wg, G, wave, lane, (PROBE_DUP == 7 && _r == 0) ? 16384 : 0); } SEAM(7); }
        if (RUN(8)) { REP(8) { const unsigned* cnt = (const unsigned*)(ws + WS_CTL) + CW_CNT + l * 4096; MoeTab M(lds); moe_tables(M, cnt, tid, lane, wave);
            UpOrder S{M, 0}; S.n = up_order_build(M, (const int*)(ws + WS_LIST), (const float*)(ws + WS_WL), wg, G, tid);
            constexpr int KU = MOE_UP_FP8 ? D / 2 : D;
            pg8::Gemm g{(const bf16*)(ws + WS_X1B), (const bf16*)(ws + WS_WUP), T, NEX * 1024, KU, KU, KU};
            EpiGluSparse E{(LAS const float*)M.wt, (bf16*)(ws + WS_HB)};
            auto S2 = MAKE_ORDER(8, S); pg8::gemm_phase_gather<EpiGluSparse, ORDER_T(8, UpOrder), MOE_UP_FP8 != 0>(lds, g, S2, E); } SEAM(8); }
        if (RUN(9)) { REP(9) { const unsigned* cnt = (const unsigned*)(ws + WS_CTL) + CW_CNT + l * 4096; MoeTab M(lds); moe_tables(M, cnt, tid, lane, wave);
            DownOrder S{M, G, wg, 8 * M.t[65]};
            constexpr int KD = MOE_DN_FP8 ? ED / 2 : ED;
            pg8::Gemm g{(const bf16*)(ws + WS_HB), (const bf16*)(ws + WS_WDN), HROWS, NEX * D, KD, KD, KD};
            EpiYexp E{(bf16*)(ws + WS_YEXP)};
            auto S2 = MAKE_ORDER(9, S); pg8::gemm_phase<EpiYexp, ORDER_T(9, DownOrder), true, true, MOE_DN_FP8 != 0>(lds, g, S2, E); } SEAM(9); }
        if (RUN(10)) { REP(10) { phase_combine_ln2(p, l, xout, l != NL - 1, gw, NGW, lane); } SEAM(10); }
#undef RUN
#undef SEAM
    }
}
__global__ void __launch_bounds__(512, 2) fwd_kernel(Params p) {
    extern __shared__ __attribute__((aligned(16))) unsigned char lds_raw[];
    LAS unsigned char* lds = (LAS unsigned char*)lds_raw;
    const int tid = threadIdx.x, lane = tid & 63, wave = __builtin_amdgcn_readfirstlane(tid >> 6);
    const int G = gridDim.x, wg = blockIdx.x, gw = wg * 8 + wave, NGW = G * 8;
    volatile LAS unsigned* MISC = (volatile LAS unsigned*)(lds + MISC_OFF);
    if (tid < 32) MISC[tid] = 0u;
    __syncthreads();
    unsigned* ctl = (unsigned*)(p.ws + WS_CTL);
    const bool multi = (p.ph_hi - p.ph_lo) > 1;
    XcdBarrier bar; bar.bar = ctl + CW_BAR; bar.x = 0; bar.st = nullptr;
    if (multi) bar = xcd_barrier_post(ctl + CW_BAR, MISC + 8);
    run_layer<0>(p, lds, bar, tid, lane, wave, G, wg, gw, NGW);
    run_layer<1>(p, lds, bar, tid, lane, wave, G, wg, gw, NGW);
}

#ifndef MK_MULTI_LAUNCH
#define MK_MULTI_LAUNCH 0
#endif
extern "C" void kernel_launch(void* const* d_in, const int* in_sizes, int n_in, void* d_out, int out_size, void* d_ws, size_t ws_size, hipStream_t stream) {
    static int grid = 0;
    if (grid == 0) {
        if (n_in != 27 || out_size != T * D || ws_size < WS_END) { fprintf(stderr, "kernel_launch: unexpected shapes (n_in %d out %d ws %zu need %zu)\n", n_in, out_size, ws_size, (size_t)WS_END); grid = -1; return; }
        int dev = 0, cus = 0, per_cu = 0;
        if (hipGetDevice(&dev) != hipSuccess || hipDeviceGetAttribute(&cus, hipDeviceAttributeMultiprocessorCount, dev) != hipSuccess) { grid = -1; return; }
        if (hipFuncSetAttribute((const void*)fwd_kernel, hipFuncAttributeMaxDynamicSharedMemorySize, LDS_BYTES) != hipSuccess) { fprintf(stderr, "kernel_launch: hipFuncSetAttribute failed\n"); grid = -1; return; }
        if (hipOccupancyMaxActiveBlocksPerMultiprocessor(&per_cu, (const void*)fwd_kernel, 512, LDS_BYTES) != hipSuccess || per_cu < 1) { fprintf(stderr, "kernel_launch: occupancy query says %d\n", per_cu); }
        (void)hipGetLastError();
        grid = cus;
    }
    if (grid < 0) return;
    (void)hipMemsetAsync((char*)d_ws + WS_CTL, 0, CTL_ZERO_BYTES, stream);
    Params p{};
    for (int i = 0; i < 27; ++i) p.in[i] = (const float*)d_in[i];
    p.out = (float*)d_out; p.ws = (unsigned char*)d_ws;
#if MK_MULTI_LAUNCH
    for (int ph = 0; ph < NL * NPH; ++ph) { p.ph_lo = ph; p.ph_hi = ph + 1; hipLaunchKernelGGL(fwd_kernel, dim3(grid), dim3(512), LDS_BYTES, stream, p); }
#else
    p.ph_lo = 0; p.ph_hi = NL * NPH; hipLaunchKernelGGL(fwd_kernel, dim3(grid), dim3(512), LDS_BYTES, stream, p);
#endif
}
```

```cpp
#include <hip/hip_runtime.h>
#include <cstdio>
#include <cstdint>
#include <type_traits>
namespace pg8 {
#define PG8_LAS __attribute__((address_space(3)))
typedef unsigned short bf16_t;
typedef short bf16x8 __attribute__((ext_vector_type(8)));
typedef float f32x4 __attribute__((ext_vector_type(4)));
typedef unsigned u32x4 __attribute__((ext_vector_type(4)));
constexpr int BM = 256, BK = 64, HALF = 128, HTB = HALF * BK * 2  , STAGE_BYTES = 8 * HTB, NXCD = 8, WGM = 8;

__host__ __device__ __forceinline__ int lds_byte(int r, int c) { const int st = (r >> 4) * 2 + (c >> 5), rr = r & 15, cc = c & 31, ob = rr * 64 + cc * 2; return st * 1024 + (ob ^ (((ob >> 9) & 1) << 5)); }
__host__ __device__ __forceinline__ void stage_rc(int b, int& R, int& C) { const int st = b / 1024, sb = b % 1024, swz = sb ^ (((sb >> 9) & 1) << 5); R = (st >> 1) * 16 + swz / 64; C = (st & 1) * 32 + (swz % 64) / 2; }
__host__ __device__ __forceinline__ int perm32(int rho) { const int n = rho >> 4, i = rho & 15; return 8 * (i >> 2) + 4 * n + (i & 3); }

struct Unit { int pm, pn, aux; };
struct Gemm { const bf16_t* A; const bf16_t* Bt; int M, N, K, lda, ldb; };

struct StaticOrder {
    int nM, nN, nwg, G, c;
    __host__ __device__ void init(int M, int N, int G_, int c_) { nM = M / BM; nN = N / BM; nwg = nM * nN; G = G_; c = c_; }
    __host__ __device__ bool next(int i, Unit& u) const {
        const long L = (long)i * G + c; if (L >= nwg) return false;
        int wgid = (int)L; { const int q = nwg / NXCD, r = nwg % NXCD, xcd = wgid % NXCD, off = wgid / NXCD; wgid = (xcd < r ? xcd * (q + 1) : r * (q + 1) + (xcd - r) * q) + off; }
        const int nig = WGM * nN, gid = wgid / nig, fm = gid * WGM, gsz = (nM - fm) < WGM ? (nM - fm) : WGM;
        u.pm = fm + ((wgid % nig) % gsz); u.pn = (wgid % nig) / gsz; return true;
    }
    __device__ __forceinline__ void a_ready(const Unit&) const {}
    __device__ __forceinline__ void done(const Unit&) const {}
};

__device__ __forceinline__ unsigned cvt_pk_bf16(float lo, float hi) { unsigned r; asm volatile("v_cvt_pk_bf16_f32 %0, %1, %2" : "=v"(r) : "v"(lo), "v"(hi)); return r; }
typedef float f32x2 __attribute__((ext_vector_type(2)));
__device__ __forceinline__ f32x2 gelu_pk(f32x2 v) {
    const f32x2 av = __builtin_elementwise_abs(v), d = av * 0.2316418882f + 1.0f;
    f32x2 t; t.x = __builtin_amdgcn_rcpf(d.x); t.y = __builtin_amdgcn_rcpf(d.y);
    f32x2 q = t * 0.5307027145f + (-0.7265760135f); q = q * t + 0.7107068705f; q = q * t + (-0.142248368f); q = q * t + 0.127414796f; q = q * t;
    const f32x2 s = (v * v) * (-0.72134752044f);
    f32x2 e; e.x = __builtin_amdgcn_exp2f(s.x); e.y = __builtin_amdgcn_exp2f(s.y);
    const f32x2 m = v * (q * e), r = v - m;
    f32x2 o; o.x = v.x < 0.f ? m.x : r.x; o.y = v.y < 0.f ? m.y : r.y; return o;
}

template <int ACT  > struct EpiBf16 {
    static constexpr bool PERM = true, AFTER_DRAIN = false; static constexpr int MID = 0; static_assert(ACT == 0 || ACT == 1, "EpiBf16: ACT is 0 (none) or 1 (gelu_pk)");
    bf16_t* O; int ldc; const float* bias; int split_cols; size_t split_stride; float scale0;
    __device__ __forceinline__ void operator()(const f32x4 (&acc)[2][2][4][2], const Unit& u, int wr, int wc, int fr, int fq) const {
        const int row0 = u.pm * BM + wr * 64 + fr; int colt = u.pn * BM; bf16_t* base = O;
        float sc = scale0; if (split_cols) { const int t = colt / split_cols; base += (size_t)t * split_stride; colt -= t * split_cols; if (t != 0) sc = 1.f; }
        const int col0 = colt + wc * 32 + 8 * fq, bcol0 = u.pn * BM + wc * 32 + 8 * fq;
        f32x4 bv[2][2];
#pragma unroll
        for (int bj = 0; bj < 2; ++bj)
#pragma unroll
            for (int n = 0; n < 2; ++n) bv[bj][n] = bias ? *(const f32x4*)(bias + bcol0 + bj * HALF + 4 * n) : (f32x4){0.f, 0.f, 0.f, 0.f};
#pragma unroll
        for (int ai = 0; ai < 2; ++ai)
#pragma unroll
            for (int m = 0; m < 4; ++m) { bf16_t* rowp = base + (size_t)(row0 + ai * HALF + m * 16) * ldc + col0;
#pragma unroll
                for (int bj = 0; bj < 2; ++bj) { f32x4 v0 = acc[ai][bj][m][0] + bv[bj][0], v1 = acc[ai][bj][m][1] + bv[bj][1];
                    if (ACT == 1) { f32x2 a = gelu_pk((f32x2){v0[0], v0[1]}), b = gelu_pk((f32x2){v0[2], v0[3]}), c = gelu_pk((f32x2){v1[0], v1[1]}), d = gelu_pk((f32x2){v1[2], v1[3]});
                        v0 = (f32x4){a.x, a.y, b.x, b.y}; v1 = (f32x4){c.x, c.y, d.x, d.y}; }
                    v0 = v0 * sc; v1 = v1 * sc; u32x4 w; w.x = cvt_pk_bf16(v0[0], v0[1]); w.y = cvt_pk_bf16(v0[2], v0[3]); w.z = cvt_pk_bf16(v1[0], v1[1]); w.w = cvt_pk_bf16(v1[2], v1[3]);
                    *(u32x4*)(rowp + bj * HALF) = w; } }
    }
};

typedef int i32x8 __attribute__((ext_vector_type(8)));
__device__ __forceinline__ i32x8 cat8(const bf16x8 a, const bf16x8 b) { typedef int i32x4 __attribute__((ext_vector_type(4))); const i32x4 x = __builtin_bit_cast(i32x4, a), y = __builtin_bit_cast(i32x4, b); return (i32x8){x[0], x[1], x[2], x[3], y[0], y[1], y[2], y[3]}; }
__device__ __forceinline__ bf16x8 lo8(const i32x8 v) { typedef int i32x4 __attribute__((ext_vector_type(4))); return __builtin_bit_cast(bf16x8, __builtin_shufflevector(v, v, 0, 1, 2, 3)); }
__device__ __forceinline__ bf16x8 hi8(const i32x8 v) { typedef int i32x4 __attribute__((ext_vector_type(4))); return __builtin_bit_cast(bf16x8, __builtin_shufflevector(v, v, 4, 5, 6, 7)); }
template <class Epi, class Sched, bool ALIGN_EPI = false, bool SP2 = false, bool FP8 = false>
__device__ __forceinline__ void gemm_phase(PG8_LAS unsigned char* lds, const Gemm g, const Sched& S, const Epi& E) {
    const int tid = threadIdx.x, wid = __builtin_amdgcn_readfirstlane(tid >> 6), lane = tid & 63, wr = wid >> 2, wc = wid & 3, fr = lane & 15, fq = lane >> 4;
    const int K = g.K, nt = K / BK;
    unsigned voffA[2], voffB[2];
#pragma unroll
    for (int i = 0; i < 2; ++i) { int R, C; stage_rc(tid * 16 + i * 8192, R, C); const int Rb = Epi::PERM ? ((R & ~31) + perm32(R & 31)) : R;
        voffA[i] = (unsigned)(R * g.lda + C) * 2u; voffB[i] = (unsigned)(Rb * g.ldb + C) * 2u; }
    const size_t kstep = (size_t)(BK * 2);
    const size_t hstepA = (size_t)HALF * g.lda * 2, hstepB = (size_t)HALF * g.ldb * 2;
    const size_t tstepA = 2 * hstepA, tstepB = 2 * hstepB;
    const unsigned ldsw = (unsigned)wid * 1024u;
    const int aoff = lds_byte(wr * 64 + fr, fq * 8), boff = lds_byte(wc * 32 + fr, fq * 8);
#define PG8_SA(b, h) (((b) * 2 + (h)) * HTB)
#define PG8_SB(b, h) ((4 + (b) * 2 + (h)) * HTB)
#define PG8_STAGE(bufoff, gbase, voff) do { _Pragma("unroll") for (int _i = 0; _i < 2; ++_i) \
        __builtin_amdgcn_global_load_lds((const unsigned*)((const char*)(gbase) + (voff)[_i]), (PG8_LAS unsigned*)(lds + (bufoff) + ldsw + _i * 8192), 16, 0, 0); } while (0)
#define PG8_LDA(dst, b, h) do { _Pragma("unroll") for (int m = 0; m < 4; ++m) { if constexpr (FP8) dst##8[m] = cat8(*(const PG8_LAS bf16x8*)(lds + PG8_SA(b, h) + aoff + m * 2048), *(const PG8_LAS bf16x8*)(lds + PG8_SA(b, h) + aoff + m * 2048 + 1024)); \
        else { _Pragma("unroll") for (int k = 0; k < 2; ++k) dst[m][k] = *(const PG8_LAS bf16x8*)(lds + PG8_SA(b, h) + aoff + m * 2048 + k * 1024); } } } while (0)
#define PG8_LDB(dst, b, h) do { _Pragma("unroll") for (int n = 0; n < 2; ++n) { if constexpr (FP8) dst##8[n] = cat8(*(const PG8_LAS bf16x8*)(lds + PG8_SB(b, h) + boff + n * 2048), *(const PG8_LAS bf16x8*)(lds + PG8_SB(b, h) + boff + n * 2048 + 1024)); \
        else { _Pragma("unroll") for (int k = 0; k < 2; ++k) dst[n][k] = *(const PG8_LAS bf16x8*)(lds + PG8_SB(b, h) + boff + n * 2048 + k * 1024); } } } while (0)
#define PG8_MMA(ai, bj, At, Bt) do { __builtin_amdgcn_s_setprio(1); _Pragma("unroll") for (int m = 0; m < 4; ++m) _Pragma("unroll") for (int n = 0; n < 2; ++n) { \
        if constexpr (FP8) asm volatile("v_mfma_scale_f32_16x16x128_f8f6f4 %0, %1, %2, %0, %3, %3 op_sel_hi:[0,0,0]" : "+v"(acc[ai][bj][m][n]) : "v"(Bt##8[n]), "v"(At##8[m]), "v"(fp8_unit_scale)); \
        else { _Pragma("unroll") for (int k = 0; k < 2; ++k) acc[ai][bj][m][n] = __builtin_amdgcn_mfma_f32_16x16x32_bf16(Bt[n][k], At[m][k], acc[ai][bj][m][n], 0, 0, 0); } } __builtin_amdgcn_s_setprio(0); } while (0)
#define PG8_WAIT_V(n) asm volatile("s_waitcnt vmcnt(" #n ")" ::: "memory")
#define PG8_WAIT_L(n) asm volatile("s_waitcnt lgkmcnt(" #n ")" ::: "memory")
#define PG8_BAR __builtin_amdgcn_s_barrier()
#define PG8_SCHED __builtin_amdgcn_sched_barrier(0)
    Unit cur, nxt; int ui = 0;
    if (!S.next(0, cur)) return;
    f32x4 acc[2][2][4][2];
#pragma unroll
    for (int a = 0; a < 2; ++a)
#pragma unroll
        for (int b = 0; b < 2; ++b)
#pragma unroll
            for (int m = 0; m < 4; ++m)
#pragma unroll
                for (int n = 0; n < 2; ++n) acc[a][b][m][n] = (f32x4){0.f, 0.f, 0.f, 0.f};
    int fp8_unit_scale = 0x7F7F7F7F; asm volatile("" : "+v"(fp8_unit_scale));
    bf16x8 At[4][2], B0[2][2], B1[2][2];
    i32x8 At8[4], B08[2], B18[2];
    const char* cA = (const char*)g.A + (size_t)cur.pm * tstepA; const char* cB = (const char*)g.Bt + (size_t)cur.pn * tstepB;
    S.a_ready(cur);
    if constexpr (SP2) {
        PG8_STAGE(PG8_SB(0, 0), cB, voffB); PG8_STAGE(PG8_SB(0, 1), cB + hstepB, voffB); PG8_STAGE(PG8_SA(0, 0), cA, voffA); PG8_STAGE(PG8_SA(0, 1), cA + hstepA, voffA);
        if (wr == 1) PG8_BAR;
        PG8_WAIT_V(2); PG8_BAR;
        PG8_STAGE(PG8_SB(1, 0), cB + kstep, voffB); PG8_STAGE(PG8_SA(1, 0), cA + kstep, voffA); PG8_STAGE(PG8_SB(1, 1), cB + hstepB + kstep, voffB);
        PG8_WAIT_V(6); PG8_BAR;
    } else {
        PG8_STAGE(PG8_SB(0, 0), cB, voffB); PG8_STAGE(PG8_SA(0, 0), cA, voffA); PG8_STAGE(PG8_SB(0, 1), cB + hstepB, voffB); PG8_STAGE(PG8_SA(0, 1), cA + hstepA, voffA);
        if (wr == 1) PG8_BAR;
        PG8_WAIT_V(4); PG8_BAR;
        PG8_STAGE(PG8_SB(1, 0), cB + kstep, voffB); PG8_STAGE(PG8_SA(1, 0), cA + kstep, voffA); PG8_STAGE(PG8_SB(1, 1), cB + hstepB + kstep, voffB);
        PG8_WAIT_V(6); PG8_BAR;
    }
    for (;;) {
        const bool has_next = S.next(ui + 1, nxt);
        const char* nA = has_next ? (const char*)g.A + (size_t)nxt.pm * tstepA : cA; const char* nB = has_next ? (const char*)g.Bt + (size_t)nxt.pn * tstepB : cB;
        for (int t = 0; t < nt; t += 2) {
            const bool last = (t == nt - 2);
            const char* a1 = cA + (size_t)(t + 1) * kstep;
            const char* a2 = last ? nA : cA + (size_t)(t + 2) * kstep; const char* b2 = last ? nB : cB + (size_t)(t + 2) * kstep;
            const char* a3 = a2 + kstep; const char* b3 = b2 + kstep;
            if (last && has_next) S.a_ready(nxt);
            if constexpr (SP2) {
            if constexpr (Epi::MID > 0) { if (t != 0 && (t % Epi::MID) == 0) { PG8_SCHED; if constexpr (FP8) asm volatile("s_nop 7\n\ts_nop 7" ::: "memory"); E.mid(acc, cur, t / Epi::MID, wr, wc, fr, fq); if constexpr (FP8) asm volatile("s_nop 7" ::: "memory"); PG8_SCHED; } }
            PG8_LDB(B0, 0, 0); PG8_LDB(B1, 0, 1); PG8_SCHED; PG8_LDA(At, 0, 0); PG8_STAGE(PG8_SA(1, 1), a1 + hstepA, voffA);
            PG8_WAIT_V(8); PG8_WAIT_L(0); PG8_BAR; PG8_MMA(0, 0, At, B0); PG8_MMA(0, 1, At, B1); PG8_BAR; PG8_SCHED;
            PG8_LDA(At, 0, 1); PG8_STAGE(PG8_SB(0, 0), b2, voffB); PG8_STAGE(PG8_SB(0, 1), b2 + hstepB, voffB); PG8_STAGE(PG8_SA(0, 0), a2, voffA);
            PG8_WAIT_V(8); PG8_WAIT_L(0); PG8_BAR; PG8_MMA(1, 0, At, B0); PG8_MMA(1, 1, At, B1); PG8_BAR; PG8_SCHED;
            PG8_LDB(B0, 1, 0); PG8_LDB(B1, 1, 1); PG8_SCHED; PG8_LDA(At, 1, 0); PG8_STAGE(PG8_SA(0, 1), a2 + hstepA, voffA);
            PG8_WAIT_V(8); PG8_WAIT_L(0); PG8_BAR; PG8_MMA(0, 0, At, B0); PG8_MMA(0, 1, At, B1); PG8_BAR; PG8_SCHED;
            PG8_LDA(At, 1, 1); PG8_STAGE(PG8_SB(1, 0), b3, voffB); PG8_STAGE(PG8_SB(1, 1), b3 + hstepB, voffB); PG8_STAGE(PG8_SA(1, 0), a3, voffA);
            PG8_WAIT_V(8); PG8_WAIT_L(0); PG8_BAR; PG8_MMA(1, 0, At, B0); PG8_MMA(1, 1, At, B1); PG8_BAR; PG8_SCHED;
            } else {
            PG8_LDB(B0, 0, 0); PG8_SCHED; PG8_LDA(At, 0, 0); PG8_STAGE(PG8_SA(1, 1), a1 + hstepA, voffA);
            PG8_WAIT_L(8); PG8_BAR; PG8_WAIT_L(0); PG8_MMA(0, 0, At, B0); PG8_BAR; PG8_SCHED;
            PG8_LDB(B1, 0, 1); PG8_STAGE(PG8_SB(0, 0), b2, voffB);
            PG8_BAR; PG8_WAIT_L(0); PG8_MMA(0, 1, At, B1); PG8_BAR;
            PG8_LDA(At, 0, 1); PG8_STAGE(PG8_SA(0, 0), a2, voffA);
            PG8_BAR; PG8_WAIT_L(0); PG8_MMA(1, 0, At, B0); PG8_BAR; PG8_SCHED;
            PG8_STAGE(PG8_SB(0, 1), b2 + hstepB, voffB);
            PG8_WAIT_V(6); PG8_BAR; PG8_MMA(1, 1, At, B1); PG8_BAR;
            PG8_LDB(B0, 1, 0); PG8_SCHED; PG8_LDA(At, 1, 0); PG8_STAGE(PG8_SA(0, 1), a2 + hstepA, voffA);
            PG8_WAIT_L(8); PG8_BAR; PG8_WAIT_L(0); PG8_MMA(0, 0, At, B0); PG8_BAR; PG8_SCHED;
            PG8_LDB(B1, 1, 1); PG8_STAGE(PG8_SB(1, 0), b3, voffB);
            PG8_BAR; PG8_WAIT_L(0); PG8_MMA(0, 1, At, B1); PG8_BAR;
            PG8_LDA(At, 1, 1); PG8_STAGE(PG8_SA(1, 0), a3, voffA);
            PG8_BAR; PG8_WAIT_L(0); PG8_MMA(1, 0, At, B0); PG8_BAR; PG8_SCHED;
            PG8_STAGE(PG8_SB(1, 1), b3 + hstepB, voffB);
            PG8_WAIT_V(6); PG8_BAR; PG8_MMA(1, 1, At, B1); PG8_BAR;
            }
        }
        if constexpr (ALIGN_EPI) { if (wr == 0) PG8_BAR; }
        if constexpr (FP8) asm volatile("s_nop 7\n\ts_nop 7" ::: "memory");
        if constexpr (!Epi::AFTER_DRAIN) { E(acc, cur, wr, wc, fr, fq); S.done(cur); }
        if (!has_next) break;
#pragma unroll
        for (int a = 0; a < 2; ++a)
#pragma unroll
            for (int b = 0; b < 2; ++b)
#pragma unroll
                for (int m = 0; m < 4; ++m)
#pragma unroll
                    for (int n = 0; n < 2; ++n) acc[a][b][m][n] = (f32x4){0.f, 0.f, 0.f, 0.f};
        cur = nxt; cA = nA; cB = nB; ++ui;
        if constexpr (ALIGN_EPI) { if (wr == 1) PG8_BAR; }
    }
    PG8_WAIT_V(0);
    if constexpr (!ALIGN_EPI) { if (wr == 0) PG8_BAR; }
    PG8_BAR;
    if constexpr (Epi::AFTER_DRAIN) { E.fused(acc, cur, wr, wc, fr, fq, lds, wid, lane); S.done(cur); }
#undef PG8_SA
#undef PG8_SB
#undef PG8_STAGE
#undef PG8_LDA
#undef PG8_LDB
#undef PG8_MMA
#undef PG8_WAIT_V
#undef PG8_WAIT_L
#undef PG8_BAR
#undef PG8_SCHED
}
template <class Epi, class Sched, bool FP8 = false>
__device__ __forceinline__ void gemm_phase_gather(PG8_LAS unsigned char* lds, const Gemm g, const Sched& S, const Epi& E) {
    const int tid = threadIdx.x, wid = __builtin_amdgcn_readfirstlane(tid >> 6), lane = tid & 63, wr = wid >> 2, wc = wid & 3, fr = lane & 15, fq = lane >> 4;
    const int K = g.K, nt = K / BK;
    unsigned voffB[2]; int RA[2], CA[2];
#pragma unroll
    for (int i = 0; i < 2; ++i) { int R, C; stage_rc(tid * 16 + i * 8192, R, C); const int Rb = Epi::PERM ? ((R & ~31) + perm32(R & 31)) : R;
        RA[i] = R; CA[i] = C; voffB[i] = (unsigned)(Rb * g.ldb + C) * 2u; }
    const size_t kstep = (size_t)(BK * 2);
    const size_t hstepB = (size_t)HALF * g.ldb * 2, tstepB = 2 * hstepB;
    const unsigned ldsw = (unsigned)wid * 1024u;
    const int aoff = lds_byte(wr * 64 + fr, fq * 8), boff = lds_byte(wc * 32 + fr, fq * 8);
#define PG8_SA(b, h) (((b) * 2 + (h)) * HTB)
#define PG8_SB(b, h) ((4 + (b) * 2 + (h)) * HTB)
#define PG8_STAGE(bufoff, gbase, voff) do { _Pragma("unroll") for (int _i = 0; _i < 2; ++_i) \
        __builtin_amdgcn_global_load_lds((const unsigned*)((const char*)(gbase) + (voff)[_i]), (PG8_LAS unsigned*)(lds + (bufoff) + ldsw + _i * 8192), 16, 0, 0); } while (0)
#define PG8_LDA(dst, b, h) do { _Pragma("unroll") for (int m = 0; m < 4; ++m) { if constexpr (FP8) dst##8[m] = cat8(*(const PG8_LAS bf16x8*)(lds + PG8_SA(b, h) + aoff + m * 2048), *(const PG8_LAS bf16x8*)(lds + PG8_SA(b, h) + aoff + m * 2048 + 1024)); \
        else { _Pragma("unroll") for (int k = 0; k < 2; ++k) dst[m][k] = *(const PG8_LAS bf16x8*)(lds + PG8_SA(b, h) + aoff + m * 2048 + k * 1024); } } } while (0)
#define PG8_LDB(dst, b, h) do { _Pragma("unroll") for (int n = 0; n < 2; ++n) { if constexpr (FP8) dst##8[n] = cat8(*(const PG8_LAS bf16x8*)(lds + PG8_SB(b, h) + boff + n * 2048), *(const PG8_LAS bf16x8*)(lds + PG8_SB(b, h) + boff + n * 2048 + 1024)); \
        else { _Pragma("unroll") for (int k = 0; k < 2; ++k) dst[n][k] = *(const PG8_LAS bf16x8*)(lds + PG8_SB(b, h) + boff + n * 2048 + k * 1024); } } } while (0)
#define PG8_MMA(ai, bj, At, Bt) do { __builtin_amdgcn_s_setprio(1); _Pragma("unroll") for (int m = 0; m < 4; ++m) _Pragma("unroll") for (int n = 0; n < 2; ++n) { \
        if constexpr (FP8) asm volatile("v_mfma_scale_f32_16x16x128_f8f6f4 %0, %1, %2, %0, %3, %3 op_sel_hi:[0,0,0]" : "+v"(acc[ai][bj][m][n]) : "v"(Bt##8[n]), "v"(At##8[m]), "v"(fp8_unit_scale)); \
        else { _Pragma("unroll") for (int k = 0; k < 2; ++k) acc[ai][bj][m][n] = __builtin_amdgcn_mfma_f32_16x16x32_bf16(Bt[n][k], At[m][k], acc[ai][bj][m][n], 0, 0, 0); } } __builtin_amdgcn_s_setprio(0); } while (0)
#define PG8_WAIT_V(n) asm volatile("s_waitcnt vmcnt(" #n ")" ::: "memory")
#define PG8_WAIT_L(n) asm volatile("s_waitcnt lgkmcnt(" #n ")" ::: "memory")
#define PG8_BAR __builtin_amdgcn_s_barrier()
#define PG8_SCHED __builtin_amdgcn_sched_barrier(0)
#define PG8_ROWS(dst, ui_) do { _Pragma("unroll") for (int _h = 0; _h < 2; ++_h) _Pragma("unroll") for (int _i = 0; _i < 2; ++_i) \
        dst[_h][_i] = (unsigned)S.row_token((ui_), _h * HALF + RA[_i]) * (unsigned)(g.lda * 2) + (unsigned)(CA[_i] * 2); } while (0)
    Unit cur, nxt; int ui = 0;
    if (!S.next(0, cur)) return;
    f32x4 acc[2][2][4][2];
#pragma unroll
    for (int a = 0; a < 2; ++a)
#pragma unroll
        for (int b = 0; b < 2; ++b)
#pragma unroll
            for (int m = 0; m < 4; ++m)
#pragma unroll
                for (int n = 0; n < 2; ++n) acc[a][b][m][n] = (f32x4){0.f, 0.f, 0.f, 0.f};
    int fp8_unit_scale = 0x7F7F7F7F; asm volatile("" : "+v"(fp8_unit_scale));
    bf16x8 At[4][2], B0[2][2], B1[2][2];
    i32x8 At8[4], B08[2], B18[2];
    unsigned offC[2][2];
    PG8_ROWS(offC, 0);
    const char* gA = (const char*)g.A;
    const char* cB = (const char*)g.Bt + (size_t)cur.pn * tstepB;
    PG8_STAGE(PG8_SB(0, 0), cB, voffB); PG8_STAGE(PG8_SB(0, 1), cB + hstepB, voffB); PG8_STAGE(PG8_SA(0, 0), gA, offC[0]); PG8_STAGE(PG8_SA(0, 1), gA, offC[1]);
    if (wr == 1) PG8_BAR;
    PG8_WAIT_V(2); PG8_BAR;
    PG8_STAGE(PG8_SB(1, 0), cB + kstep, voffB); PG8_STAGE(PG8_SA(1, 0), gA + kstep, offC[0]); PG8_STAGE(PG8_SB(1, 1), cB + hstepB + kstep, voffB);
    PG8_WAIT_V(6); PG8_BAR;
    for (;;) {
        const bool has_next = S.next(ui + 1, nxt);
        const char* nB = has_next ? (const char*)g.Bt + (size_t)nxt.pn * tstepB : cB;
        for (int t = 0; t < nt; t += 2) {
            const bool last = (t == nt - 2);
            const char* a1 = gA + (size_t)(t + 1) * kstep;
            const char* a2 = last ? gA : gA + (size_t)(t + 2) * kstep; const char* b2 = last ? nB : cB + (size_t)(t + 2) * kstep;
            const char* a3 = a2 + kstep; const char* b3 = b2 + kstep;
            PG8_LDB(B0, 0, 0); PG8_LDB(B1, 0, 1); PG8_SCHED; PG8_LDA(At, 0, 0); PG8_STAGE(PG8_SA(1, 1), a1, offC[1]);
            if (last && has_next) { PG8_ROWS(offC, ui + 1); }
            PG8_WAIT_V(8); PG8_WAIT_L(0); PG8_BAR; PG8_MMA(0, 0, At, B0); PG8_MMA(0, 1, At, B1); PG8_BAR; PG8_SCHED;
            PG8_LDA(At, 0, 1); PG8_STAGE(PG8_SB(0, 0), b2, voffB); PG8_STAGE(PG8_SB(0, 1), b2 + hstepB, voffB); PG8_STAGE(PG8_SA(0, 0), a2, offC[0]);
            PG8_WAIT_V(8); PG8_WAIT_L(0); PG8_BAR; PG8_MMA(1, 0, At, B0); PG8_MMA(1, 1, At, B1); PG8_BAR; PG8_SCHED;
            PG8_LDB(B0, 1, 0); PG8_LDB(B1, 1, 1); PG8_SCHED; PG8_LDA(At, 1, 0); PG8_STAGE(PG8_SA(0, 1), a2, offC[1]);
            PG8_WAIT_V(8); PG8_WAIT_L(0); PG8_BAR; PG8_MMA(0, 0, At, B0); PG8_MMA(0, 1, At, B1); PG8_BAR; PG8_SCHED;
            PG8_LDA(At, 1, 1); PG8_STAGE(PG8_SB(1, 0), b3, voffB); PG8_STAGE(PG8_SB(1, 1), b3 + hstepB, voffB); PG8_STAGE(PG8_SA(1, 0), a3, offC[0]);
            PG8_WAIT_V(8); PG8_WAIT_L(0); PG8_BAR; PG8_MMA(1, 0, At, B0); PG8_MMA(1, 1, At, B1); PG8_BAR; PG8_SCHED;
        }
        if (wr == 0) PG8_BAR;
        if constexpr (FP8) asm volatile("s_nop 7\n\ts_nop 7" ::: "memory");
        E(acc, cur, wr, wc, fr, fq); S.done(cur);
        if (!has_next) break;
#pragma unroll
        for (int a = 0; a < 2; ++a)
#pragma unroll
            for (int b = 0; b < 2; ++b)
#pragma unroll
                for (int m = 0; m < 4; ++m)
#pragma unroll
                    for (int n = 0; n < 2; ++n) acc[a][b][m][n] = (f32x4){0.f, 0.f, 0.f, 0.f};
        cur = nxt; cB = nB; ++ui;
        if (wr == 1) PG8_BAR;
    }
    PG8_WAIT_V(0);
    PG8_BAR;
#undef PG8_ROWS
#undef PG8_SA
#undef PG8_SB
#undef PG8_STAGE
#undef PG8_LDA
#undef PG8_LDB
#undef PG8_MMA
#undef PG8_WAIT_V
#undef PG8_WAIT_L
#undef PG8_BAR
#undef PG8_SCHED
}
}

#ifndef CONV_SKIP
#define CONV_SKIP 6
#endif
#ifndef MERGE_FP8
#define MERGE_FP8 1
#endif
#ifndef MOE_DN_FP8
#define MOE_DN_FP8 1
#endif
#ifndef MOE_UP_FP8
#define MOE_UP_FP8 1
#endif
#ifndef PROBE_NOATOM
#define PROBE_NOATOM 0
#endif
constexpr int T = 8192, D = 2048, NL = 2, BW = 512, ZC = 14336, INC = 14352;
constexpr int NE = 64, NEX = 65  , ED = 512;
constexpr int BRW = 4 * BW;
constexpr int HK = NEX * ED;
constexpr float ALPHA = 1.41421356237f;
constexpr float LN_EPS = 1e-5f;
constexpr float UPSC = MOE_UP_FP8 ? (1.f / 64.f) : 1.f;
constexpr float BRSC = MERGE_FP8 ? 8.f : 1.f, MGSC = MERGE_FP8 ? (1.f / (8.f * 64.f)) : 1.f;
constexpr float HSC = 8.f, DNSC = MOE_DN_FP8 ? (1.f / (HSC * 64.f)) : 1.f;
constexpr int ZC_SBQ = 0, ZC_SBK = 512, ZC_SBV = 1024, ZC_GMU = 1536, ZC_GMV = 2048, ZC_GDN = 2560, ZC_GDNG = 4096,
              ZC_MLQ = 4608, ZC_MLK = 4864, ZC_MLV = 5120, ZC_MLO = 5632, ZC_GATE = 6144;

#define GAS __attribute__((address_space(1)))
#define LAS __attribute__((address_space(3)))
typedef unsigned short bf16;
typedef unsigned v4u __attribute__((ext_vector_type(4)));
typedef unsigned v2u __attribute__((ext_vector_type(2)));
typedef float v4f __attribute__((ext_vector_type(4)));
typedef float v2f __attribute__((ext_vector_type(2)));
#define LDS_WAIT() asm volatile("s_waitcnt lgkmcnt(0)" ::: "memory")
#define LDS_BAR() do { asm volatile("s_waitcnt lgkmcnt(0)" ::: "memory"); __builtin_amdgcn_s_barrier(); asm volatile("" ::: "memory"); } while (0)

constexpr size_t MiB = 1u << 20;
constexpr size_t WS_CTL = 0, CTL_ZERO_BYTES = 1 * MiB;
constexpr size_t WS_WIN = 2 * MiB, WS_WBR = 58 * MiB, WS_WOUT = 66 * MiB, WS_WUP = 74 * MiB, WS_WDN = 334 * MiB;
constexpr size_t WS_XB = 464 * MiB, WS_SMALL = 496 * MiB, WS_EG = 497 * MiB, WS_BETA = WS_EG + 256 * 1024, WS_COMB = 498 * MiB;
constexpr size_t WS_Z = 500 * MiB, WS_GQ = 724 * MiB, WS_GK = 740 * MiB, WS_GV = 756 * MiB, WS_GO = 772 * MiB, WS_HO = 788 * MiB;
constexpr size_t WS_BR = 804 * MiB, WS_MTMP = 836 * MiB, WS_MSUM = 900 * MiB, WS_Y = 932 * MiB, WS_X1 = 996 * MiB, WS_X1B = 1060 * MiB;
constexpr size_t WS_XCUR = 1092 * MiB, WS_HB = 1156 * MiB, WS_YEXP = 1236 * MiB, WS_LIST = 1524 * MiB, WS_WL = 1526 * MiB, WS_SLOT = 1528 * MiB, WS_MQ = 1530 * MiB, WS_MS = 1534 * MiB, WS_MK = 1538 * MiB, WS_MV = 1542 * MiB, WS_MFL = 1552 * MiB, WS_HDEN = WS_MFL + 65536, WS_VT = 1553 * MiB, WS_END = 1561 * MiB;
constexpr size_t WS_GU = WS_GQ, WS_GNW = WS_GK, WS_GQG = WS_GK + 8 * MiB, WS_GKT = WS_GV, WS_GAT = WS_GV + 8 * MiB, WS_GDL = WS_GV + 12 * MiB;
constexpr int HROWS = 73728;
static_assert(WS_HB + (size_t)HROWS * ED * 2 <= WS_YEXP && WS_YEXP + (size_t)HROWS * D * 2 <= WS_LIST, "ws map (moe)");
static_assert(WS_WIN + (size_t)ZC * D * 2 <= WS_WBR && WS_WUP + (size_t)NEX * 1024 * D * 2 <= WS_WDN && WS_WDN + (size_t)D * HK * 2 <= WS_XB, "ws map (weights)");
static_assert(WS_Z + (size_t)T * ZC * 2 <= WS_GQ, "ws map (acts)");
constexpr int CW_BAR = 4096, CW_CNT = 16384;
constexpr int TAB_OFF = 131072 + 1024;
constexpr int LDS_BYTES = 163840, MISC_OFF = 131072 + 320;

__device__ __forceinline__ float bflo(unsigned w) { return __uint_as_float(w << 16); }
__device__ __forceinline__ float bfhi(unsigned w) { return __uint_as_float(w & 0xffff0000u); }
__device__ __forceinline__ unsigned f2bf(float f) { unsigned u = __float_as_uint(f); return (u + 0x7fffu + ((u >> 16) & 1u)) >> 16; }
typedef __bf16 bf16n2 __attribute__((ext_vector_type(2))); typedef float f32n2 __attribute__((ext_vector_type(2)));
__device__ __forceinline__ unsigned pk2(float lo, float hi) { const bf16n2 v = __builtin_convertvector((f32n2){lo, hi}, bf16n2); return __builtin_bit_cast(unsigned, v); }
__device__ __forceinline__ unsigned pk4_f8(float a, float b, float c, float d, float sc) {
    a = __builtin_amdgcn_fmed3f(a * sc, -448.f, 448.f); b = __builtin_amdgcn_fmed3f(b * sc, -448.f, 448.f); c = __builtin_amdgcn_fmed3f(c * sc, -448.f, 448.f); d = __builtin_amdgcn_fmed3f(d * sc, -448.f, 448.f);
    unsigned w = 0; w = __builtin_amdgcn_cvt_pk_fp8_f32(a, b, w, false); w = __builtin_amdgcn_cvt_pk_fp8_f32(c, d, w, true); return w; }
__device__ __forceinline__ v4f ld4(const void* base, size_t idx, bool is_bf16) {
    if (is_bf16) { const v2u r = *(const v2u*)((const unsigned short*)base + idx); return (v4f){bflo(r.x), bfhi(r.x), bflo(r.y), bfhi(r.y)}; }
    return *(const v4f*)((const float*)base + idx); }
template <int CTRL> __device__ __forceinline__ float dpp(float x) { return __builtin_bit_cast(float, __builtin_amdgcn_mov_dpp(__builtin_bit_cast(int, x), CTRL, 0xf, 0xf, true)); }
__device__ __forceinline__ float sum4(float x) { x += dpp<0xB1>(x); x += dpp<0x4E>(x); return x; }
__device__ __forceinline__ float sum8(float x) { x = sum4(x); x += dpp<0x141>(x); return x; }
__device__ __forceinline__ float sum16(float x) { x = sum8(x); x += dpp<0x140>(x); return x; }
__device__ __forceinline__ float wave_sum(float x) { x = sum16(x); x += __shfl_xor(x, 16); x += __shfl_xor(x, 32); return x; }
__device__ __forceinline__ float max8(float x) { x = fmaxf(x, dpp<0xB1>(x)); x = fmaxf(x, dpp<0x4E>(x)); x = fmaxf(x, dpp<0x141>(x)); return x; }
__device__ __forceinline__ float min8(float x) { x = fminf(x, dpp<0xB1>(x)); x = fminf(x, dpp<0x4E>(x)); x = fminf(x, dpp<0x141>(x)); return x; }
__device__ __forceinline__ float wave_scan_incl(float v) {
    v += __builtin_bit_cast(float, __builtin_amdgcn_update_dpp(0, __builtin_bit_cast(int, v), 0x111, 0xf, 0xf, true));
    v += __builtin_bit_cast(float, __builtin_amdgcn_update_dpp(0, __builtin_bit_cast(int, v), 0x112, 0xf, 0xf, true));
    v += __builtin_bit_cast(float, __builtin_amdgcn_update_dpp(0, __builtin_bit_cast(int, v), 0x114, 0xf, 0xf, true));
    v += __builtin_bit_cast(float, __builtin_amdgcn_update_dpp(0, __builtin_bit_cast(int, v), 0x118, 0xf, 0xf, true));
    v += __builtin_bit_cast(float, __builtin_amdgcn_update_dpp(0, __builtin_bit_cast(int, v), 0x142, 0xa, 0xf, false));
    v += __builtin_bit_cast(float, __builtin_amdgcn_update_dpp(0, __builtin_bit_cast(int, v), 0x143, 0xc, 0xf, false));
    return v;
}
__device__ __forceinline__ float sigmoidf_(float x) { return __builtin_amdgcn_rcpf(1.f + __expf(-x)); }
__device__ __forceinline__ float sigmoid_div(float x) { return 1.f / (1.f + __expf(-x)); }
__device__ __forceinline__ float siluf_(float x) { return x * __builtin_amdgcn_rcpf(1.f + __expf(-x)); }
__device__ __forceinline__ float softplusf_(float x) { return fmaxf(x, 0.f) + __logf(1.f + __expf(-fabsf(x))); }
__device__ __forceinline__ float gelu_tanh(float x) { const float y = 0.7978845608f * (x + 0.044715f * x * x * x); const float t = 1.f - 2.f * __builtin_amdgcn_rcpf(__expf(2.f * y) + 1.f); return 0.5f * x * (1.f + t); }
__device__ __forceinline__ void unpack8(const v4u r, float (&f)[8]) { f[0] = bflo(r.x); f[1] = bfhi(r.x); f[2] = bflo(r.y); f[3] = bfhi(r.y); f[4] = bflo(r.z); f[5] = bfhi(r.z); f[6] = bflo(r.w); f[7] = bfhi(r.w); }
#define XB_TMO      128
#define XB_XCNT(j)  (256  + 64 * (j))
#define XB_XSUB(j)  (1280 + 64 * (j))
#define XB_XGEN(j)  (2304 + 64 * (j))
#define XB_TOP      3328
#define XB_TOPGEN   3392
#define XCD_BAR_WORDS 3456
#define XB_SPIN_CAP (1u << 18)

__device__ __forceinline__ unsigned xb_ld(unsigned* p)              { return __hip_atomic_load(p, __ATOMIC_RELAXED, __HIP_MEMORY_SCOPE_AGENT); }
__device__ __forceinline__ unsigned xb_add(unsigned* p, unsigned v) { return __hip_atomic_fetch_add(p, v, __ATOMIC_RELAXED, __HIP_MEMORY_SCOPE_AGENT); }
__device__ __forceinline__ unsigned xb_xcc_id() { return (unsigned)__builtin_amdgcn_s_getreg((3 << 11) | 20) & 0xFu; }
#define XB_SPIN(cond, bar) do { unsigned _sp = 0; while (cond) { __builtin_amdgcn_s_sleep(1); \
    if ((++_sp & 255u) == 0u) { if (xb_ld(&(bar)[XB_TMO])) break; if (_sp > XB_SPIN_CAP) { atomicAdd(&(bar)[XB_TMO], 1u); break; } } } } while (0)

struct XcdBarrier {
    unsigned* bar; unsigned x;
    volatile LAS unsigned* st;
};

__device__ __forceinline__ XcdBarrier xcd_barrier_post(unsigned* bar, volatile LAS unsigned* st) {
    XcdBarrier b; b.bar = bar; b.x = xb_xcc_id(); b.st = st;
    if (threadIdx.x == 0) (void)xb_add(&bar[XB_XCNT(b.x)], 1u);
    return b;
}
__device__ __forceinline__ void xcd_barrier_complete(unsigned* bar, unsigned x, unsigned& nloc, unsigned& nx) {
    const unsigned G = gridDim.x * gridDim.y * gridDim.z;
    unsigned sum, cnt, mine, sp = 0u;
    for (;;) {
        sum = 0u; cnt = 0u; mine = 0u;
#pragma unroll
        for (unsigned j = 0; j < 16; ++j) { const unsigned c = xb_ld(&bar[XB_XCNT(j)]); sum += c; cnt += (c > 0u) ? 1u : 0u; mine = (j == x) ? c : mine; }
        if (sum == G) break;
        __builtin_amdgcn_s_sleep(1);
        if ((++sp & 255u) == 0u) { if (xb_ld(&bar[XB_TMO])) break; if (sp > XB_SPIN_CAP) { atomicAdd(&bar[XB_TMO], 1u); break; } }
    }
    nloc = mine > 0u ? mine : 1u; nx = cnt > 0u ? cnt : 1u;
}

__device__ __forceinline__ void xcd_barrier(const XcdBarrier& b) {
    asm volatile("s_waitcnt vmcnt(0)" ::: "memory");
    __syncthreads();
    if (threadIdx.x == 0) {
        unsigned* bar = b.bar;
        __builtin_amdgcn_s_waitcnt(0);
        unsigned nloc = b.st[0], nx = b.st[1];
        if (nloc == 0u) { xcd_barrier_complete(bar, b.x, nloc, nx); b.st[0] = nloc; b.st[1] = nx; }
        const unsigned old = xb_add(&bar[XB_XSUB(b.x)], 1u);
        const unsigned gen = old / nloc;
        if (old + 1u == (gen + 1u) * nloc) {
            __builtin_amdgcn_fence(__ATOMIC_RELEASE, "agent");
            asm volatile("s_waitcnt vmcnt(0)" ::: "memory");
            const unsigned og = xb_add(&bar[XB_TOP], 1u);
            const unsigned tg = og / nx;
            if (og + 1u == (tg + 1u) * nx) xb_add(&bar[XB_TOPGEN], 1u);
            else XB_SPIN(xb_ld(&bar[XB_TOPGEN]) == tg, bar);
            __builtin_amdgcn_fence(__ATOMIC_ACQUIRE, "agent");
            xb_add(&bar[XB_XGEN(b.x)], 1u);
            asm volatile("s_waitcnt vmcnt(0)" ::: "memory");
        } else {
            XB_SPIN(xb_ld(&bar[XB_XGEN(b.x)]) == gen, bar);
            __builtin_amdgcn_fence(__ATOMIC_ACQUIRE, "agent");
            asm volatile("s_waitcnt vmcnt(0)" ::: "memory");
        }
    }
    __syncthreads();
}

struct Params { const float* in[27]; float* out; unsigned char* ws; int ph_lo, ph_hi; };
enum { I_X = 0, I_WIN, I_GMNG, I_GMNB, I_GMWS, I_GMBS, I_CONVW, I_ALOG, I_DTB, I_GDNNG, I_MLIB, I_MLFB, I_MLNG, I_WBR, I_WOUT, I_LN1G, I_LN1B,
       I_WR, I_RB, I_WG, I_WU, I_WD, I_SG, I_SU, I_SD, I_LN2G, I_LN2B };

using pg8::f32x4; using pg8::u32x4; using pg8::Unit; using pg8::HALF; using pg8::BM;

struct EpiMergeH {
    static constexpr bool PERM = true, AFTER_DRAIN = false; static constexpr int MID = MERGE_FP8 ? BW / (2 * pg8::BK) : BW / pg8::BK;
    const bf16* Z; bf16* msum;
    __device__ __forceinline__ void mid(f32x4 (&acc)[2][2][4][2], const Unit& u, int j, int wr, int wc, int fr, int fq) const {
        int row0 = u.pm * BM + wr * 64 + fr; const int col0 = u.pn * BM + wc * 32 + 8 * fq; asm volatile("" : "+v"(row0));
        const bf16* zp = Z + ZC_GATE + (size_t)(j - 1) * D + col0;
#pragma unroll
        for (int am = 0; am < 4; ++am) { const int ai = am >> 1, m0 = (am & 1) * 2; v4u ga[2][2], gb[2][2];
#pragma unroll
            for (int m = 0; m < 2; ++m)
#pragma unroll
                for (int bj = 0; bj < 2; ++bj) { const bf16* q = zp + (size_t)(row0 + ai * HALF + (m0 + m) * 16) * ZC + bj * HALF; ga[m][bj] = *(const v4u*)q; gb[m][bj] = *(const v4u*)(q + D); }
#pragma unroll
            for (int m = 0; m < 2; ++m)
#pragma unroll
                for (int bj = 0; bj < 2; ++bj) { float a[8], b[8]; unpack8(ga[m][bj], a); unpack8(gb[m][bj], b);
#pragma unroll
                    for (int i = 0; i < 8; ++i) { const float ea = __builtin_amdgcn_exp2f(fmaxf(a[i], -60.f) * -1.44269504f), eb = __builtin_amdgcn_exp2f(fmaxf(b[i], -60.f) * -1.44269504f);
                        acc[ai][bj][m0 + m][i >> 2][i & 3] *= (1.f + eb) * __builtin_amdgcn_rcpf(1.f + ea); } }
            asm volatile("" ::: "memory"); }
    }
    __device__ __forceinline__ void operator()(const f32x4 (&acc)[2][2][4][2], const Unit& u, int wr, int wc, int fr, int fq) const {
        const int row0 = u.pm * BM + wr * 64 + fr, col0 = u.pn * BM + wc * 32 + 8 * fq;
#pragma unroll
        for (int ai = 0; ai < 2; ++ai) { v4u gg[4][2];
#pragma unroll
            for (int m = 0; m < 4; ++m)
#pragma unroll
                for (int bj = 0; bj < 2; ++bj) gg[m][bj] = *(const v4u*)(Z + (size_t)(row0 + ai * HALF + m * 16) * ZC + ZC_GATE + 3 * D + col0 + bj * HALF);
#pragma unroll
            for (int m = 0; m < 4; ++m)
#pragma unroll
                for (int bj = 0; bj < 2; ++bj) { const size_t row = (size_t)(row0 + ai * HALF + m * 16); const int col = col0 + bj * HALF; float gl[8]; unpack8(gg[m][bj], gl);
                    f32x4 v0 = acc[ai][bj][m][0], v1 = acc[ai][bj][m][1];
#pragma unroll
                    for (int j = 0; j < 4; ++j) { v0[j] *= sigmoidf_(gl[j]) * MGSC; v1[j] *= sigmoidf_(gl[4 + j]) * MGSC; }
                    unsigned w0 = 0, w1 = 0; w0 = __builtin_amdgcn_cvt_pk_fp8_f32(v0[0], v0[1], w0, false); w0 = __builtin_amdgcn_cvt_pk_fp8_f32(v0[2], v0[3], w0, true); w1 = __builtin_amdgcn_cvt_pk_fp8_f32(v1[0], v1[1], w1, false); w1 = __builtin_amdgcn_cvt_pk_fp8_f32(v1[2], v1[3], w1, true);
                    *(v2u*)((unsigned char*)msum + row * D + col) = (v2u){w0, w1}; }
            asm volatile("" ::: "memory"); }
    }
};
struct EpiResid {
    static constexpr bool PERM = true, AFTER_DRAIN = false; static constexpr int MID = 0;
    const void* X; bf16* Y; float sc; bool xbf;
    __device__ __forceinline__ void operator()(const f32x4 (&acc)[2][2][4][2], const Unit& u, int wr, int wc, int fr, int fq) const {
        const int row0 = u.pm * BM + wr * 64 + fr, col0 = u.pn * BM + wc * 32 + 8 * fq;
#pragma unroll
        for (int ai = 0; ai < 2; ++ai)
#pragma unroll
            for (int m = 0; m < 4; ++m) { const size_t off = (size_t)(row0 + ai * HALF + m * 16) * D + col0;
#pragma unroll
                for (int bj = 0; bj < 2; ++bj) { const f32x4 x0 = ld4(X, off + bj * HALF, xbf), x1 = ld4(X, off + bj * HALF + 4, xbf);
                    const f32x4 v0 = x0 * ALPHA + acc[ai][bj][m][0] * sc, v1 = x1 * ALPHA + acc[ai][bj][m][1] * sc;
                    u32x4 w; w.x = pk2(v0[0], v0[1]); w.y = pk2(v0[2], v0[3]); w.z = pk2(v1[0], v1[1]); w.w = pk2(v1[2], v1[3]); *(u32x4*)(Y + off + bj * HALF) = w; } }
    }
};
struct MoeTab {
    LAS int* t; LAS unsigned short* tok; LAS float* wt; LAS unsigned char* mte;
    __device__ __forceinline__ MoeTab(LAS unsigned char* lds) : t((LAS int*)(lds + TAB_OFF)), tok((LAS unsigned short*)(lds + TAB_OFF + 1024)), wt((LAS float*)(lds + TAB_OFF + 5120)), mte((LAS unsigned char*)(lds + TAB_OFF + 13312)) {}
};
__device__ __forceinline__ void moe_tables(const MoeTab& M, const unsigned* cnt  , int tid, int lane, int wave) {
    __syncthreads();
    if (wave == 0) { const int c = (int)cnt[64 * lane]; const int tiles = (c + 255) >> 8; const float incl = wave_scan_incl((float)tiles);
        M.t[80 + lane] = c; M.t[lane] = (int)incl - tiles; if (lane == 63) { M.t[64] = (int)incl; M.t[65] = (int)incl + T / 256; M.t[80 + 64] = T; } }
    __syncthreads();
    const int Mt = M.t[65];
    for (int mt = tid; mt < Mt; mt += 512) { int e = 0;
        for (int k = 1; k <= 64; ++k) e = (M.t[k] <= mt) ? k : e;
        M.mte[mt] = (unsigned char)e; }
    __syncthreads();
}
struct UpOrder {
    MoeTab M; int n;
    __device__ __forceinline__ bool next(int i, Unit& u) const { if (i >= n) return false; u.pm = M.t[168 + i]; u.pn = M.t[176 + i]; u.aux = i; return true; }
    __device__ __forceinline__ int row_token(int i, int r) const { return (int)M.tok[i * 256 + r]; }
    __device__ __forceinline__ void a_ready(const Unit&) const {}
    __device__ __forceinline__ void done(const Unit&) const {}
};
__device__ __forceinline__ int up_order_build(const MoeTab& M, const int* LIST, const float* WL, int wg, int G, int tid) {
    const int U = 4 * M.t[65];
    if (tid < 8) { const int L = tid * G + wg; if (L < U) { const int mt = L >> 2, q = L & 3, e = M.mte[mt]; M.t[168 + tid] = mt; M.t[176 + tid] = e * 4 + q; M.t[184 + tid] = e; M.t[192 + tid] = mt - M.t[e]; } }
    int n = 0;
#pragma unroll
    for (int i = 0; i < 8; ++i) n += (i * G + wg < U) ? 1 : 0;
    __syncthreads();
    for (int idx = tid; idx < n * 256; idx += 512) { const int i = idx >> 8, r = idx & 255, e = M.t[184 + i], li = M.t[192 + i] * 256 + r;
        int tk = 0; float w = 0.f;
        if (e < NE) { if (li < M.t[80 + e]) { tk = LIST[e * T + li]; w = WL[e * T + li]; } } else { tk = li; w = 1.f; }
        M.tok[idx] = (unsigned short)tk; M.wt[idx] = w; }
    __syncthreads();
    return n;
}
struct EpiGluSparse {
    static constexpr bool PERM = true, AFTER_DRAIN = false; static constexpr int MID = 0;
    LAS const float* wt; bf16* H;
    __device__ __forceinline__ void operator()(const f32x4 (&acc)[2][2][4][2], const Unit& u, int wr, int wc, int fr, int fq) const {
        const int q = u.pn & 3; const int rl0 = wr * 64 + fr, col0 = q * 128 + wc * 32 + 8 * fq;
#pragma unroll
        for (int ai = 0; ai < 2; ++ai)
#pragma unroll
            for (int m = 0; m < 4; ++m) { const int rl = rl0 + ai * HALF + m * 16; const float c = wt[u.aux * 256 + rl]; float h[8];
#pragma unroll
                for (int n = 0; n < 2; ++n)
#pragma unroll
                    for (int j = 0; j < 4; ++j) h[4 * n + j] = siluf_(acc[ai][0][m][n][j] * UPSC) * (acc[ai][1][m][n][j] * UPSC) * c;
#if MOE_DN_FP8
#pragma unroll
                for (int j = 0; j < 8; ++j) h[j] = __builtin_amdgcn_fmed3f(h[j] * HSC, -448.f, 448.f);
                unsigned w0 = 0, w1 = 0; w0 = __builtin_amdgcn_cvt_pk_fp8_f32(h[0], h[1], w0, false); w0 = __builtin_amdgcn_cvt_pk_fp8_f32(h[2], h[3], w0, true); w1 = __builtin_amdgcn_cvt_pk_fp8_f32(h[4], h[5], w1, false); w1 = __builtin_amdgcn_cvt_pk_fp8_f32(h[6], h[7], w1, true);
                *(v2u*)((unsigned char*)H + ((size_t)u.pm * 256 + rl) * ED + col0) = (v2u){w0, w1}; }
#else
                u32x4 w; w.x = pk2(h[0], h[1]); w.y = pk2(h[2], h[3]); w.z = pk2(h[4], h[5]); w.w = pk2(h[6], h[7]);
                *(u32x4*)(H + ((size_t)u.pm * 256 + rl) * ED + col0) = w; }
#endif
    }
};
struct DownOrder {
    MoeTab M; int G, c, U;
    __device__ __forceinline__ bool next(int i, Unit& u) const { const int L = i * G + c; if (L >= U) return false; const int mt = L >> 3; u.pm = mt; u.pn = (int)M.mte[mt] * 8 + (L & 7); u.aux = 0; return true; }
    __device__ __forceinline__ void a_ready(const Unit&) const {}
    __device__ __forceinline__ void done(const Unit&) const {}
};
struct EpiYexp {
    static constexpr bool PERM = true, AFTER_DRAIN = false; static constexpr int MID = 0;
    bf16* Y;
    __device__ __forceinline__ void operator()(const f32x4 (&acc)[2][2][4][2], const Unit& u, int wr, int wc, int fr, int fq) const {
        const int row0 = u.pm * BM + wr * 64 + fr, col0 = (u.pn & 7) * BM + wc * 32 + 8 * fq;
#pragma unroll
        for (int ai = 0; ai < 2; ++ai)
#pragma unroll
            for (int m = 0; m < 4; ++m) { bf16* rowp = Y + (size_t)(row0 + ai * HALF + m * 16) * D + col0;
#pragma unroll
                for (int bj = 0; bj < 2; ++bj) { const f32x4 v0 = acc[ai][bj][m][0] * DNSC, v1 = acc[ai][bj][m][1] * DNSC;
                    u32x4 w; w.x = pk2(v0[0], v0[1]); w.y = pk2(v0[2], v0[3]); w.z = pk2(v1[0], v1[1]); w.w = pk2(v1[2], v1[3]); *(u32x4*)(rowp + bj * HALF) = w; } }
    }
};

struct TrItem { const float* src; bf16* dst; unsigned sld, dld; int f8; };
__device__ __forceinline__ void tr_load(const TrItem& t, int lane, v4f (&v)[8]) { const int r8 = lane >> 3, c4 = lane & 7;
#pragma unroll
    for (int i = 0; i < 8; ++i) v[i] = *(const v4f*)(t.src + (size_t)(8 * i + r8) * t.sld + 4 * c4); }
__device__ __forceinline__ void tr_store(const TrItem& t, const v4f (&v)[8], LAS float* scr, int lane, bool nostore = false) {
    { const int r8 = lane >> 3, c4 = lane & 7;
#pragma unroll
      for (int i = 0; i < 8; ++i) { LAS float* d = scr + (8 * i + r8) * 33 + 4 * c4; d[0] = v[i].x; d[1] = v[i].y; d[2] = v[i].z; d[3] = v[i].w; } }
    LDS_WAIT(); asm volatile("" ::: "memory");
    if (nostore) return;
    if (t.f8) {
        const int c = lane & 3;
#pragma unroll
        for (int j = 0; j < 2; ++j) { const int n = (lane >> 2) + 16 * j; const LAS float* s = scr + (16 * c) * 33 + n; unsigned w[4];
#pragma unroll
            for (int q = 0; q < 4; ++q) { unsigned x = 0; x = __builtin_amdgcn_cvt_pk_fp8_f32(s[(4 * q) * 33] * 64.f, s[(4 * q + 1) * 33] * 64.f, x, false); x = __builtin_amdgcn_cvt_pk_fp8_f32(s[(4 * q + 2) * 33] * 64.f, s[(4 * q + 3) * 33] * 64.f, x, true); w[q] = x; }
            *(v4u*)((unsigned char*)t.dst + (size_t)n * t.dld + 16 * c) = (v4u){w[0], w[1], w[2], w[3]}; }
    } else {
        const int c = lane & 7;
#pragma unroll
        for (int j = 0; j < 4; ++j) { const int n = (lane >> 3) + 8 * j; const LAS float* s = scr + (8 * c) * 33 + n;
            v4u o; o.x = pk2(s[0 * 33], s[1 * 33]); o.y = pk2(s[2 * 33], s[3 * 33]); o.z = pk2(s[4 * 33], s[5 * 33]); o.w = pk2(s[6 * 33], s[7 * 33]);
            *(v4u*)(t.dst + (size_t)n * t.dld + 8 * c) = o; }
    }
    LDS_WAIT(); asm volatile("" ::: "memory");
}
template <int PART> __device__ __forceinline__ TrItem tr_decode(const Params& p, int l, int it) {
    unsigned char* ws = p.ws;
    constexpr int N_IN = (ZC / 32) * (D / 64), N_BR = 4 * (BW / 64) * (D / 32), N_OUT = (D / 64) * (D / 32), N_UP = NEX * 2 * (D / 64) * (ED / 32);
    int r = it; TrItem t; t.f8 = 0;
    if (PART == 0) {
        const float* w_in = p.in[I_WIN] + (size_t)l * D * INC; const float* w_br = p.in[I_WBR] + (size_t)l * 4 * BW * D; const float* w_out = p.in[I_WOUT] + (size_t)l * D * D;
        bf16* WIN = (bf16*)(ws + WS_WIN); bf16* WBR = (bf16*)(ws + WS_WBR); bf16* WOUT = (bf16*)(ws + WS_WOUT);
        if (r < N_IN) { const int kb = r / (ZC / 32), n0 = (r % (ZC / 32)) * 32, k0 = kb * 64; const int sc = n0 + (n0 >= ZC_GATE ? 16 : (n0 >= ZC_MLQ ? 8 : 0));
            t.src = w_in + (size_t)k0 * INC + sc; t.sld = INC; t.dst = (bf16*)((unsigned char*)WIN + (size_t)n0 * D + k0); t.dld = D; t.f8 = 1; return t; } r -= N_IN;
        if (r < N_BR) { const int g = r / 512, rr = r % 512, k0 = (rr / 64) * 64, n0 = (rr % 64) * 32;
            t.src = w_br + ((size_t)g * BW + k0) * D + n0; t.sld = D;
#if MERGE_FP8
            t.dst = (bf16*)((unsigned char*)WBR + (size_t)n0 * BRW + g * BW + k0); t.dld = BRW; t.f8 = 1; return t; }
#else
            t.dst = WBR + (size_t)n0 * BRW + g * BW + k0; t.dld = BRW; return t; }
#endif
        r -= N_BR;
        { const int k0 = (r / 64) * 64, n0 = (r % 64) * 32; t.src = w_out + (size_t)k0 * D + n0; t.sld = D; t.dst = (bf16*)((unsigned char*)WOUT + (size_t)n0 * D + k0); t.dld = D; t.f8 = 1; return t; }
    } else {
        const float* w_g = p.in[I_WG] + (size_t)l * NE * D * ED; const float* w_u = p.in[I_WU] + (size_t)l * NE * D * ED; const float* w_d = p.in[I_WD] + (size_t)l * NE * ED * D;
        const float* s_g = p.in[I_SG] + (size_t)l * D * ED; const float* s_u = p.in[I_SU] + (size_t)l * D * ED; const float* s_d = p.in[I_SD] + (size_t)l * ED * D;
        bf16* WUP = (bf16*)(ws + WS_WUP); bf16* WDN = (bf16*)(ws + WS_WDN);
        if (r < N_UP) { const int e = r / 1024, rr = r % 1024, mat = rr / 512, r2 = rr % 512, k0 = (r2 / 16) * 64, n0 = (r2 % 16) * 32;
            const float* sb = (e < NE) ? ((mat ? w_u : w_g) + (size_t)e * D * ED) : (mat ? s_u : s_g);
            const int drow = e * 1024 + (n0 / 128) * 256 + mat * 128 + (n0 % 128);
            t.src = sb + (size_t)k0 * ED + n0; t.sld = ED;
#if MOE_UP_FP8
            t.dst = (bf16*)((unsigned char*)WUP + (size_t)drow * D + k0); t.dld = D; t.f8 = 1; return t; }
#else
            t.dst = WUP + (size_t)drow * D + k0; t.dld = D; return t; }
#endif
        r -= N_UP;
        { const int e = r / 512, rr = r % 512, k0 = (rr / 64) * 64, n0 = (rr % 64) * 32;
            const float* sb = (e < NE) ? (w_d + (size_t)e * ED * D) : s_d;
            t.src = sb + (size_t)k0 * D + n0; t.sld = D;
#if MOE_DN_FP8
            t.dst = (bf16*)((unsigned char*)WDN + ((size_t)e * D + n0) * ED + k0); t.dld = ED; t.f8 = 1; return t; }
#else
            t.dst = WDN + ((size_t)e * D + n0) * ED + k0; t.dld = ED; return t; }
#endif
    }
}
template <int PART> __device__ __forceinline__ void phase_convert(const Params& p, int l, LAS unsigned char* lds, int gw, int NGW, int wave, int lane, bool nostore = false, int lo = 0, int hi = 1 << 30) {
    constexpr int N_IN = (ZC / 32) * (D / 64), N_BR = 4 * (BW / 64) * (D / 32), N_OUT = (D / 64) * (D / 32), N_UP = NEX * 2 * (D / 64) * (ED / 32), N_DN = NEX * (ED / 64) * (D / 32);
    constexpr int NITEMS = (PART == 0) ? (N_IN + N_BR + N_OUT) : (N_UP + N_DN);
    LAS float* scr = (LAS float*)(lds + wave * 16384);
    const int NIT = hi < NITEMS ? hi : NITEMS;
    if (lo + gw >= NIT) return;
    TrItem cur = tr_decode<PART>(p, l, lo + gw); v4f va[8], vb[8];
    tr_load(cur, lane, va);
    for (int it = lo + gw; it < NIT; it += 2 * NGW) {
        const int i1 = it + NGW, i2 = it + 2 * NGW; TrItem nx = cur;
        if (i1 < NIT) { nx = tr_decode<PART>(p, l, i1); } tr_load(nx, lane, vb);
        tr_store(cur, va, scr, lane, nostore);
        if (i1 >= NIT) break;
        cur = nx; if (i2 < NIT) { cur = tr_decode<PART>(p, l, i2); } tr_load(cur, lane, va);
        tr_store(nx, vb, scr, lane, nostore);
        if (i2 >= NIT) break;
    }
}
__device__ __forceinline__ void phase_xprep(const Params& p, int l, const void* xin, bool xbf, LAS unsigned char* lds, int gw, int NGW, int tid, int lane) {
    const float* w_in = p.in[I_WIN] + (size_t)l * D * INC;
    constexpr int XP = 2052; LAS float* xt = (LAS float*)lds; LAS float* part = (LAS float*)lds;
    const int wave = tid >> 6, n_l = lane & 15, kq = lane >> 4, wg = gw >> 3, G = NGW >> 3;
    const int colw = n_l < 8 ? 4608 + n_l : 6152 + (n_l - 8);
    float bw[64];
#pragma unroll
    for (int q = 0; q < 64; ++q) bw[q] = w_in[(size_t)(256 * wave + 16 * (q >> 2) + 4 * kq + (q & 3)) * INC + colw];
    unsigned char* XB = p.ws + WS_XB; float* SMALL = (float*)(p.ws + WS_SMALL);
    __syncthreads();
    for (int tg = wg; tg < T / 16; tg += G) {
        {   v4f va[8], vb[8]; const size_t m0 = (size_t)tg * 16 + 2 * wave;
#pragma unroll
            for (int j = 0; j < 8; ++j) { va[j] = ld4(xin, m0 * D + 4 * lane + 256 * j, xbf); vb[j] = ld4(xin, (m0 + 1) * D + 4 * lane + 256 * j, xbf); }
#pragma unroll
            for (int rr = 0; rr < 2; ++rr) { unsigned* xo = (unsigned*)(XB + (m0 + rr) * D) + lane;
#pragma unroll
                for (int j = 0; j < 8; ++j) { const v4f v = rr ? vb[j] : va[j]; unsigned w = 0; w = __builtin_amdgcn_cvt_pk_fp8_f32(v.x, v.y, w, false); w = __builtin_amdgcn_cvt_pk_fp8_f32(v.z, v.w, w, true); xo[64 * j] = w;
                    *(LAS v4f*)(xt + (2 * wave + rr) * XP + 4 * lane + 256 * j) = v; } } }
        __syncthreads();
        {   pg8::f32x4 acc[4];
#pragma unroll
            for (int i = 0; i < 4; ++i) acc[i] = (pg8::f32x4){0.f, 0.f, 0.f, 0.f};
            const LAS float* xa = xt + n_l * XP + 256 * wave + 4 * kq;
#pragma unroll
            for (int s2 = 0; s2 < 16; ++s2) { const v4f a4 = *(const LAS v4f*)(xa + 16 * s2);
                acc[0] = __builtin_amdgcn_mfma_f32_16x16x4f32(a4.x, bw[4 * s2 + 0], acc[0], 0, 0, 0); acc[1] = __builtin_amdgcn_mfma_f32_16x16x4f32(a4.y, bw[4 * s2 + 1], acc[1], 0, 0, 0);
                acc[2] = __builtin_amdgcn_mfma_f32_16x16x4f32(a4.z, bw[4 * s2 + 2], acc[2], 0, 0, 0); acc[3] = __builtin_amdgcn_mfma_f32_16x16x4f32(a4.w, bw[4 * s2 + 3], acc[3], 0, 0, 0); }
            const pg8::f32x4 tot = (acc[0] + acc[1]) + (acc[2] + acc[3]);
            __syncthreads();
#pragma unroll
            for (int j = 0; j < 4; ++j) part[(wave * 16 + 4 * kq + j) * 16 + n_l] = tot[j]; }
        __syncthreads();
        if (tid < 256) { float a = 0.f;
#pragma unroll
            for (int w = 0; w < 8; ++w) a += part[w * 256 + tid];
            SMALL[(size_t)tg * 256 + tid] = a; }
        __syncthreads();
    }
}


typedef short bf16x8_t __attribute__((ext_vector_type(8)));
__device__ __forceinline__ void ml_pre_item(const Params& p, int l, LAS unsigned char* lds, int item, int tid, int wave, int lane) {
    const int h = item & 3, n = item >> 2; const size_t t0 = (size_t)n * 64;
    const bf16* Z = (const bf16*)(p.ws + WS_Z); const float* SMALL = (const float*)(p.ws + WS_SMALL);
    bf16* MQ = (bf16*)(p.ws + WS_MQ) + (size_t)item * 4096; bf16* MS = (bf16*)(p.ws + WS_MS) + (size_t)item * 4096; bf16* MK = (bf16*)(p.ws + WS_MK) + (size_t)item * 4096;
    bf16* MV = (bf16*)(p.ws + WS_MV) + (size_t)item * 9216; float* MFL = (float*)(p.ws + WS_MFL);
    LAS float* qs = (LAS float*)lds;
    LAS float* ks = qs + 64 * 65;
    LAS float* bs = ks + 64 * 65;
    LAS unsigned short* vs = (LAS unsigned short*)(bs + 128);
    { const int tk = tid >> 3, c8 = tid & 7; float f[8];
      unpack8(*(const v4u*)(Z + (t0 + tk) * ZC + ZC_MLQ + h * 64 + 8 * c8), f);
#pragma unroll
      for (int i = 0; i < 8; ++i) qs[tk * 65 + 8 * c8 + i] = f[i];
      unpack8(*(const v4u*)(Z + (t0 + tk) * ZC + ZC_MLK + h * 64 + 8 * c8), f);
#pragma unroll
      for (int i = 0; i < 8; ++i) ks[tk * 65 + 8 * c8 + i] = f[i]; }
#pragma unroll
    for (int r = 0; r < 2; ++r) { const int idx = tid + 512 * r, tk = idx >> 4, c8 = idx & 15;
        *(LAS v4u*)(vs + tk * 136 + 8 * c8) = *(const v4u*)(Z + (t0 + tk) * ZC + ZC_MLV + h * 128 + 8 * c8); }
    if (wave == 0) { const float fp = SMALL[(t0 + lane) * 16 + 12 + h] + p.in[I_MLFB][l * 4 + h]; const float lf = -softplusf_(-fp);
        bs[lane] = wave_scan_incl(lf); bs[64 + lane] = SMALL[(t0 + lane) * 16 + 8 + h] + p.in[I_MLIB][l * 4 + h]; }
    __syncthreads();
    const float blast = bs[63];
    { const int i = tid >> 3, jb = tid & 7; const float bi = bs[i];
      { const float e = __expf(bi) * 0.125f; float o[8];
#pragma unroll
        for (int x = 0; x < 8; ++x) o[x] = qs[i * 65 + 8 * jb + x] * e;
        v4u w; w.x = pk2(o[0], o[1]); w.y = pk2(o[2], o[3]); w.z = pk2(o[4], o[5]); w.w = pk2(o[6], o[7]); *(v4u*)(MQ + i * 64 + 8 * jb) = w; }
      {
          const int ti = wave >> 1, c16 = lane & 15, g4 = lane >> 4, i2 = 16 * ti + c16; const float bi2 = bs[i2];
#define ML_F8(dst, base) do { const LAS float* _b = (base); const v4u _w = (v4u){pg8::cvt_pk_bf16(_b[0], _b[1]), pg8::cvt_pk_bf16(_b[2], _b[3]), pg8::cvt_pk_bf16(_b[4], _b[5]), pg8::cvt_pk_bf16(_b[6], _b[7])}; dst = __builtin_bit_cast(bf16x8_t, _w); } while (0)
          bf16x8_t bq[2];
#pragma unroll
          for (int s2 = 0; s2 < 2; ++s2) ML_F8(bq[s2], qs + i2 * 65 + 32 * s2 + 8 * g4);
#pragma unroll
          for (int jj = 0; jj < 2; ++jj) { const int tj = 2 * (wave & 1) + jj; v2u sw = (v2u){0u, 0u};
              if (tj <= ti) { pg8::f32x4 d = {0.f, 0.f, 0.f, 0.f};
#pragma unroll
                  for (int s2 = 0; s2 < 2; ++s2) { bf16x8_t a; ML_F8(a, ks + (16 * tj + c16) * 65 + 32 * s2 + 8 * g4); d = __builtin_amdgcn_mfma_f32_16x16x32_bf16(a, bq[s2], d, 0, 0, 0); }
                  float v4[4];
#pragma unroll
                  for (int r = 0; r < 4; ++r) { const int j = 16 * tj + 4 * g4 + r; v4[r] = (j <= i2) ? __expf(bi2 - bs[j] + bs[64 + j]) * d[r] * 0.125f : 0.f; }
                  sw = (v2u){pk2(v4[0], v4[1]), pk2(v4[2], v4[3])}; }
              *(v2u*)(MS + i2 * 64 + 16 * tj + 4 * g4) = sw; }
#undef ML_F8
      }
      { float o[8];
#pragma unroll
        for (int x = 0; x < 8; ++x) { const int j = 8 * jb + x; o[x] = ks[j * 65 + i] * __expf(blast - bs[j] + bs[64 + j]); }
        v4u w; w.x = pk2(o[0], o[1]); w.y = pk2(o[2], o[3]); w.z = pk2(o[4], o[5]); w.w = pk2(o[6], o[7]); *(v4u*)(MK + i * 64 + 8 * jb) = w; }
    }
    { const int c = tid >> 2, jq = tid & 3; unsigned w[8];
#pragma unroll
      for (int x = 0; x < 8; ++x) w[x] = (unsigned)vs[(16 * jq + 2 * x) * 136 + c] | ((unsigned)vs[(16 * jq + 2 * x + 1) * 136 + c] << 16);
      *(v4u*)(MV + c * 64 + 16 * jq) = (v4u){w[0], w[1], w[2], w[3]}; *(v4u*)(MV + c * 64 + 16 * jq + 8) = (v4u){w[4], w[5], w[6], w[7]};
      if (tid < 64) { const int c2 = 128 + (tid >> 2); const unsigned one = (c2 == 128) ? 0x3F803F80u : 0u;
          *(v4u*)(MV + c2 * 64 + 16 * jq) = (v4u){one, one, one, one}; *(v4u*)(MV + c2 * 64 + 16 * jq + 8) = (v4u){one, one, one, one}; } }
    if (tid == 0) MFL[item] = __expf(blast);
    __syncthreads();
}
struct MlFrags { bf16x8_t q[2], s[2], kt[2], vt[2]; float fl; };
__device__ __forceinline__ void ml_load(MlFrags& F, const Params& p, int item, int offA, int offV) {
    const bf16* MQ = (const bf16*)(p.ws + WS_MQ) + (size_t)item * 4096; const bf16* MS = (const bf16*)(p.ws + WS_MS) + (size_t)item * 4096; const bf16* MK = (const bf16*)(p.ws + WS_MK) + (size_t)item * 4096;
    const bf16* MV = (const bf16*)(p.ws + WS_MV) + (size_t)item * 9216;
#pragma unroll
    for (int ks = 0; ks < 2; ++ks) { F.q[ks] = *(const bf16x8_t*)(MQ + offA + 32 * ks); F.s[ks] = *(const bf16x8_t*)(MS + offA + 32 * ks); F.kt[ks] = *(const bf16x8_t*)(MK + offA + 32 * ks); F.vt[ks] = *(const bf16x8_t*)(MV + offV + 32 * ks); }
    F.fl = ((const float*)(p.ws + WS_MFL))[item];
}
__device__ __forceinline__ void ml_seq(const Params& p, LAS unsigned char* lds, int wgi, int wave, int lane) {
    const int u = wgi * 2 + (wave >> 2), wi = wave & 3, h = u / 9, sl = u % 9, g = lane >> 4, c = lane & 15;
    LAS unsigned short* CT = (LAS unsigned short*)(lds + (wave >> 2) * 4096);
    float* HO = (float*)(p.ws + WS_HO); float* HDEN = (float*)(p.ws + WS_HDEN);
    const int offA = (16 * wi + c) * 64 + 8 * g, offV = (16 * sl + c) * 64 + 8 * g;
    *(LAS v2u*)(CT + c * 64 + 16 * wi + 4 * g) = (v2u){0u, 0u};
    pg8::f32x4 Cacc = {0.f, 0.f, 0.f, 0.f};
    __syncthreads();
    MlFrags F0, F1;
    ml_load(F0, p, h, offA, offV);
#define ML_STEP(F, n_) do { const int cur = (n_) & 1; \
        const bf16x8_t c0 = *(const LAS bf16x8_t*)(CT + cur * 1024 + c * 64 + 8 * g), c1 = *(const LAS bf16x8_t*)(CT + cur * 1024 + c * 64 + 32 + 8 * g); \
        pg8::f32x4 num = {0.f, 0.f, 0.f, 0.f}; \
        num = __builtin_amdgcn_mfma_f32_16x16x32_bf16(F.q[0], c0, num, 0, 0, 0); num = __builtin_amdgcn_mfma_f32_16x16x32_bf16(F.q[1], c1, num, 0, 0, 0); \
        num = __builtin_amdgcn_mfma_f32_16x16x32_bf16(F.s[0], F.vt[0], num, 0, 0, 0); num = __builtin_amdgcn_mfma_f32_16x16x32_bf16(F.s[1], F.vt[1], num, 0, 0, 0); \
        Cacc = Cacc * F.fl; \
        Cacc = __builtin_amdgcn_mfma_f32_16x16x32_bf16(F.kt[0], F.vt[0], Cacc, 0, 0, 0); Cacc = __builtin_amdgcn_mfma_f32_16x16x32_bf16(F.kt[1], F.vt[1], Cacc, 0, 0, 0); \
        { v2u w; w.x = pk2(Cacc[0], Cacc[1]); w.y = pk2(Cacc[2], Cacc[3]); *(LAS v2u*)(CT + (cur ^ 1) * 1024 + c * 64 + 16 * wi + 4 * g) = w; } \
        { const size_t tb = (size_t)(n_) * 64 + 16 * wi + 4 * g; \
          if (sl < 8) { _Pragma("unroll") for (int r = 0; r < 4; ++r) HO[(tb + r) * BW + h * 128 + 16 * sl + c] = num[r]; } \
          else if (c == 0) { _Pragma("unroll") for (int r = 0; r < 4; ++r) HDEN[(tb + r) * 4 + h] = num[r]; } } \
        LDS_BAR(); } while (0)
    for (int n = 0; n < T / 64; n += 2) {
        ml_load(F1, p, (n + 1) * 4 + h, offA, offV);
        ML_STEP(F0, n);
        ml_load(F0, p, ((n + 2 < T / 64) ? n + 2 : n) * 4 + h, offA, offV);
        ML_STEP(F1, n + 1);
    }
#undef ML_STEP
}


constexpr int QP = 132;
__device__ __forceinline__ void gdn_pre_item(const Params& p, int l, LAS unsigned char* lds, int item, int tid, int wave, int lane) {
    const int h = item & 3, n = item >> 2; const size_t t0 = (size_t)n * 64;
    const bf16* Z = (const bf16*)(p.ws + WS_Z); const float* SMALL = (const float*)(p.ws + WS_SMALL);
    float* GU = (float*)(p.ws + WS_GU) + (size_t)item * 8192; bf16* GNW = (bf16*)(p.ws + WS_GNW) + (size_t)item * 8192; bf16* GQG = (bf16*)(p.ws + WS_GQG) + (size_t)item * 8192;
    bf16* GAT = (bf16*)(p.ws + WS_GAT) + (size_t)item * 4096; bf16* GKT = (bf16*)(p.ws + WS_GKT) + (size_t)item * 8192; float* GDL = (float*)(p.ws + WS_GDL);
    const float* cw = p.in[I_CONVW] + (size_t)l * 4 * 1536;
    LAS float* qs = (LAS float*)lds; LAS float* ks = qs + 64 * QP; LAS float* vs = ks + 64 * QP; LAS float* Ls = vs + 64 * QP;   LAS float* gcs = Ls + 64 * 68; LAS float* bts = gcs + 64; LAS float* btg = bts + 64;
    LAS unsigned short* zq = (LAS unsigned short*)(lds + 131584); LAS unsigned short* zk = (LAS unsigned short*)Ls; LAS unsigned short* zv = (LAS unsigned short*)vs; LAS float* cwl = btg + 64;
    float gate_b = 0.f, gate_a = 0.f; if (wave == 0) { gate_b = SMALL[(t0 + lane) * 16 + h]; gate_a = SMALL[(t0 + lane) * 16 + 4 + h]; }
    {   v4u zr[7]; v4f wr4 = (v4f){0.f, 0.f, 0.f, 0.f};
#pragma unroll
        for (int q = 0; q < 7; ++q) { const int idx = tid + 512 * q; zr[q] = (v4u){0u, 0u, 0u, 0u};
            if (idx < 3216) { const int seg = idx / 1072, rem = idx % 1072, r = rem >> 4, c16 = rem & 15; const long tt = (long)t0 - 3 + r;
                if (tt >= 0) zr[q] = *(const v4u*)(Z + (size_t)tt * ZC + ZC_GDN + seg * 512 + h * 128 + 8 * c16); } }
        if (tid < 384) { const int j = tid / 96, rest = tid % 96, i = rest >> 5, c4 = rest & 31; wr4 = *(const v4f*)(cw + j * 1536 + i * 512 + h * 128 + 4 * c4); }
#pragma unroll
        for (int q = 0; q < 7; ++q) { const int idx = tid + 512 * q;
            if (idx < 3216) { const int seg = idx / 1072, rem = idx % 1072; LAS unsigned short* zb = seg == 0 ? zq : (seg == 1 ? zk : zv); *(LAS v4u*)(zb + 8 * rem) = zr[q]; } }
        if (tid < 384) *(LAS v4f*)(cwl + 4 * tid) = wr4;
    }
    __syncthreads();
    { const int tk = tid >> 3, part = tid & 7; float av[16];
#pragma unroll 1
      for (int i = 0; i < 3; ++i) { float a[16]; const LAS unsigned short* zb = i == 0 ? zq : (i == 1 ? zk : zv);
#pragma unroll
        for (int x = 0; x < 16; ++x) a[x] = 0.f;
#pragma unroll
        for (int j = 0; j < 4; ++j) { const LAS unsigned short* src = zb + (tk + j) * 128 + 16 * part; float x0[8], x1[8]; unpack8(*(const LAS v4u*)src, x0); unpack8(*(const LAS v4u*)(src + 8), x1);
            const LAS float* wp = cwl + (j * 3 + i) * 128 + 16 * part;
#pragma unroll
            for (int x4 = 0; x4 < 2; ++x4) { const v4f w0 = *(const LAS v4f*)(wp + 4 * x4), w1 = *(const LAS v4f*)(wp + 8 + 4 * x4);
                a[4 * x4] += w0.x * x0[4 * x4]; a[4 * x4 + 1] += w0.y * x0[4 * x4 + 1]; a[4 * x4 + 2] += w0.z * x0[4 * x4 + 2]; a[4 * x4 + 3] += w0.w * x0[4 * x4 + 3];
                a[8 + 4 * x4] += w1.x * x1[4 * x4]; a[8 + 4 * x4 + 1] += w1.y * x1[4 * x4 + 1]; a[8 + 4 * x4 + 2] += w1.z * x1[4 * x4 + 2]; a[8 + 4 * x4 + 3] += w1.w * x1[4 * x4 + 3]; } }
        float ss = 0.f;
#pragma unroll
        for (int x = 0; x < 16; ++x) { a[x] = siluf_(a[x]); ss += a[x] * a[x]; }
        if (i < 2) { ss = sum8(ss); const float r = rsqrtf(ss + 1e-6f) * (i == 0 ? 0.08838834764831845f : 1.f);
#pragma unroll
            for (int x = 0; x < 16; ++x) a[x] *= r;
            LAS float* dst = (i == 0 ? qs : ks) + tk * QP + 16 * part;
#pragma unroll
            for (int x4 = 0; x4 < 4; ++x4) *(LAS v4f*)(dst + 4 * x4) = (v4f){a[4 * x4], a[4 * x4 + 1], a[4 * x4 + 2], a[4 * x4 + 3]}; }
        else {
#pragma unroll
            for (int x = 0; x < 16; ++x) av[x] = a[x]; } }
      __syncthreads();
      { LAS float* dst = vs + tk * QP + 16 * part;
#pragma unroll
        for (int x4 = 0; x4 < 4; ++x4) *(LAS v4f*)(dst + 4 * x4) = (v4f){av[4 * x4], av[4 * x4 + 1], av[4 * x4 + 2], av[4 * x4 + 3]}; } }
    if (wave == 0) { const float bb = gate_b, aa = gate_a;
        const float g = -__expf(p.in[I_ALOG][l * 4 + h]) * softplusf_(aa + p.in[I_DTB][l * 4 + h]);
        const float gc = wave_scan_incl(g), bt = sigmoidf_(bb); gcs[lane] = gc; bts[lane] = bt; btg[lane] = bt * __expf(gc); }
    __syncthreads();
    { const int ti = wave >> 1, c16 = lane & 15, g4 = lane >> 4, i = 16 * ti + c16; const float gi = gcs[i], bi = bts[i];
#define GDN_F8(dst, base) do { const v4f _a = *(const LAS v4f*)(base), _b = *(const LAS v4f*)((base) + 4); const v4u _w = (v4u){pg8::cvt_pk_bf16(_a.x, _a.y), pg8::cvt_pk_bf16(_a.z, _a.w), pg8::cvt_pk_bf16(_b.x, _b.y), pg8::cvt_pk_bf16(_b.z, _b.w)}; dst = __builtin_bit_cast(bf16x8_t, _w); } while (0)
      bf16x8_t bk[4], bq[4];
#pragma unroll
      for (int s4 = 0; s4 < 4; ++s4) { GDN_F8(bk[s4], ks + i * QP + 32 * s4 + 8 * g4); GDN_F8(bq[s4], qs + i * QP + 32 * s4 + 8 * g4); }
#pragma unroll
      for (int jj = 0; jj < 2; ++jj) { const int tj = 2 * (wave & 1) + jj; v4f lv = (v4f){0.f, 0.f, 0.f, 0.f}; v2u aw = (v2u){0u, 0u};
          if (tj <= ti) { pg8::f32x4 dk = {0.f, 0.f, 0.f, 0.f}, dq = {0.f, 0.f, 0.f, 0.f};
#pragma unroll
              for (int s4 = 0; s4 < 4; ++s4) { bf16x8_t a; GDN_F8(a, ks + (16 * tj + c16) * QP + 32 * s4 + 8 * g4);
                  dk = __builtin_amdgcn_mfma_f32_16x16x32_bf16(a, bk[s4], dk, 0, 0, 0); dq = __builtin_amdgcn_mfma_f32_16x16x32_bf16(a, bq[s4], dq, 0, 0, 0); }
              float l4[4], a4[4];
#pragma unroll
              for (int r = 0; r < 4; ++r) { const int j = 16 * tj + 4 * g4 + r; const float dc = __expf(gi - gcs[j]); l4[r] = (j < i) ? bi * dk[r] * dc : 0.f; a4[r] = (j <= i) ? dq[r] * dc : 0.f; }
              lv = (v4f){l4[0], l4[1], l4[2], l4[3]}; aw = (v2u){pk2(a4[0], a4[1]), pk2(a4[2], a4[3])}; }
          *(LAS v4f*)(Ls + i * 68 + 16 * tj + 4 * g4) = lv; *(v2u*)(GAT + i * 64 + 16 * tj + 4 * g4) = aw; }
#undef GDN_F8
    }
    __syncthreads();
    if (tid < 256) {
        const int c = tid; int vz; asm volatile("v_mov_b32 %0, 0" : "=v"(vz));
        const LAS float* rp = (c < 128) ? (vs + c) : (ks + (c - 128)); const LAS float* mp = ((c < 128) ? bts : btg) + vz;
#define GDN_RHS(i) (rp[(i) * QP] * mp[(i)])
#define GDN_L4(i, j4) (*(const LAS v4f*)(Ls + (i) * 68 + 4 * (j4) + vz))
        float x0 = GDN_RHS(0); __builtin_amdgcn_sched_barrier(0);
        float x1 = GDN_RHS(1); { const v4f l0 = GDN_L4(1, 0); __builtin_amdgcn_sched_barrier(0); x1 -= l0.x * x0; } __builtin_amdgcn_sched_barrier(0);
        float x2 = GDN_RHS(2); { const v4f l0 = GDN_L4(2, 0); __builtin_amdgcn_sched_barrier(0); x2 -= l0.x * x0; x2 -= l0.y * x1; } __builtin_amdgcn_sched_barrier(0);
        float x3 = GDN_RHS(3); { const v4f l0 = GDN_L4(3, 0); __builtin_amdgcn_sched_barrier(0); x3 -= l0.x * x0; x3 -= l0.y * x1; x3 -= l0.z * x2; } __builtin_amdgcn_sched_barrier(0);
        float x4 = GDN_RHS(4); { const v4f l0 = GDN_L4(4, 0); __builtin_amdgcn_sched_barrier(0); x4 -= l0.x * x0; x4 -= l0.y * x1; x4 -= l0.z * x2; x4 -= l0.w * x3; } __builtin_amdgcn_sched_barrier(0);
        float x5 = GDN_RHS(5); { const v4f l0 = GDN_L4(5, 0); const v4f l1 = GDN_L4(5, 1); __builtin_amdgcn_sched_barrier(0); x5 -= l0.x * x0; x5 -= l0.y * x1; x5 -= l0.z * x2; x5 -= l0.w * x3; x5 -= l1.x * x4; } __builtin_amdgcn_sched_barrier(0);
        float x6 = GDN_RHS(6); { const v4f l0 = GDN_L4(6, 0); const v4f l1 = GDN_L4(6, 1); __builtin_amdgcn_sched_barrier(0); x6 -= l0.x * x0; x6 -= l0.y * x1; x6 -= l0.z * x2; x6 -= l0.w * x3; x6 -= l1.x * x4; x6 -= l1.y * x5; } __builtin_amdgcn_sched_barrier(0);
        float x7 = GDN_RHS(7); { const v4f l0 = GDN_L4(7, 0); const v4f l1 = GDN_L4(7, 1); __builtin_amdgcn_sched_barrier(0); x7 -= l0.x * x0; x7 -= l0.y * x1; x7 -= l0.z * x2; x7 -= l0.w * x3; x7 -= l1.x * x4; x7 -= l1.y * x5; x7 -= l1.z * x6; } __builtin_amdgcn_sched_barrier(0);
        float x8 = GDN_RHS(8); { const v4f l0 = GDN_L4(8, 0); const v4f l1 = GDN_L4(8, 1); __builtin_amdgcn_sched_barrier(0); x8 -= l0.x * x0; x8 -= l0.y * x1; x8 -= l0.z * x2; x8 -= l0.w * x3; x8 -= l1.x * x4; x8 -= l1.y * x5; x8 -= l1.z * x6; x8 -= l1.w * x7; } __builtin_amdgcn_sched_barrier(0);
        float x9 = GDN_RHS(9); { const v4f l0 = GDN_L4(9, 0); const v4f l1 = GDN_L4(9, 1); const v4f l2 = GDN_L4(9, 2); __builtin_amdgcn_sched_barrier(0); x9 -= l0.x * x0; x9 -= l0.y * x1; x9 -= l0.z * x2; x9 -= l0.w * x3; x9 -= l1.x * x4; x9 -= l1.y * x5; x9 -= l1.z * x6; x9 -= l1.w * x7; x9 -= l2.x * x8; } __builtin_amdgcn_sched_barrier(0);
        float x10 = GDN_RHS(10); { const v4f l0 = GDN_L4(10, 0); const v4f l1 = GDN_L4(10, 1); const v4f l2 = GDN_L4(10, 2); __builtin_amdgcn_sched_barrier(0); x10 -= l0.x * x0; x10 -= l0.y * x1; x10 -= l0.z * x2; x10 -= l0.w * x3; x10 -= l1.x * x4; x10 -= l1.y * x5; x10 -= l1.z * x6; x10 -= l1.w * x7; x10 -= l2.x * x8; x10 -= l2.y * x9; } __builtin_amdgcn_sched_barrier(0);
        float x11 = GDN_RHS(11); { const v4f l0 = GDN_L4(11, 0); const v4f l1 = GDN_L4(11, 1); const v4f l2 = GDN_L4(11, 2); __builtin_amdgcn_sched_barrier(0); x11 -= l0.x * x0; x11 -= l0.y * x1; x11 -= l0.z * x2; x11 -= l0.w * x3; x11 -= l1.x * x4; x11 -= l1.y * x5; x11 -= l1.z * x6; x11 -= l1.w * x7; x11 -= l2.x * x8; x11 -= l2.y * x9; x11 -= l2.z * x10; } __builtin_amdgcn_sched_barrier(0);
        float x12 = GDN_RHS(12); { const v4f l0 = GDN_L4(12, 0); const v4f l1 = GDN_L4(12, 1); const v4f l2 = GDN_L4(12, 2); __builtin_amdgcn_sched_barrier(0); x12 -= l0.x * x0; x12 -= l0.y * x1; x12 -= l0.z * x2; x12 -= l0.w * x3; x12 -= l1.x * x4; x12 -= l1.y * x5; x12 -= l1.z * x6; x12 -= l1.w * x7; x12 -= l2.x * x8; x12 -= l2.y * x9; x12 -= l2.z * x10; x12 -= l2.w * x11; } __builtin_amdgcn_sched_barrier(0);
        float x13 = GDN_RHS(13); { const v4f l0 = GDN_L4(13, 0); const v4f l1 = GDN_L4(13, 1); const v4f l2 = GDN_L4(13, 2); const v4f l3 = GDN_L4(13, 3); __builtin_amdgcn_sched_barrier(0); x13 -= l0.x * x0; x13 -= l0.y * x1; x13 -= l0.z * x2; x13 -= l0.w * x3; x13 -= l1.x * x4; x13 -= l1.y * x5; x13 -= l1.z * x6; x13 -= l1.w * x7; x13 -= l2.x * x8; x13 -= l2.y * x9; x13 -= l2.z * x10; x13 -= l2.w * x11; x13 -= l3.x * x12; } __builtin_amdgcn_sched_barrier(0);
        float x14 = GDN_RHS(14); { const v4f l0 = GDN_L4(14, 0); const v4f l1 = GDN_L4(14, 1); const v4f l2 = GDN_L4(14, 2); const v4f l3 = GDN_L4(14, 3); __builtin_amdgcn_sched_barrier(0); x14 -= l0.x * x0; x14 -= l0.y * x1; x14 -= l0.z * x2; x14 -= l0.w * x3; x14 -= l1.x * x4; x14 -= l1.y * x5; x14 -= l1.z * x6; x14 -= l1.w * x7; x14 -= l2.x * x8; x14 -= l2.y * x9; x14 -= l2.z * x10; x14 -= l2.w * x11; x14 -= l3.x * x12; x14 -= l3.y * x13; } __builtin_amdgcn_sched_barrier(0);
        float x15 = GDN_RHS(15); { const v4f l0 = GDN_L4(15, 0); const v4f l1 = GDN_L4(15, 1); const v4f l2 = GDN_L4(15, 2); const v4f l3 = GDN_L4(15, 3); __builtin_amdgcn_sched_barrier(0); x15 -= l0.x * x0; x15 -= l0.y * x1; x15 -= l0.z * x2; x15 -= l0.w * x3; x15 -= l1.x * x4; x15 -= l1.y * x5; x15 -= l1.z * x6; x15 -= l1.w * x7; x15 -= l2.x * x8; x15 -= l2.y * x9; x15 -= l2.z * x10; x15 -= l2.w * x11; x15 -= l3.x * x12; x15 -= l3.y * x13; x15 -= l3.z * x14; } __builtin_amdgcn_sched_barrier(0);
        float x16 = GDN_RHS(16); { const v4f l0 = GDN_L4(16, 0); const v4f l1 = GDN_L4(16, 1); const v4f l2 = GDN_L4(16, 2); const v4f l3 = GDN_L4(16, 3); __builtin_amdgcn_sched_barrier(0); x16 -= l0.x * x0; x16 -= l0.y * x1; x16 -= l0.z * x2; x16 -= l0.w * x3; x16 -= l1.x * x4; x16 -= l1.y * x5; x16 -= l1.z * x6; x16 -= l1.w * x7; x16 -= l2.x * x8; x16 -= l2.y * x9; x16 -= l2.z * x10; x16 -= l2.w * x11; x16 -= l3.x * x12; x16 -= l3.y * x13; x16 -= l3.z * x14; x16 -= l3.w * x15; } __builtin_amdgcn_sched_barrier(0);
        float x17 = GDN_RHS(17); { const v4f l0 = GDN_L4(17, 0); const v4f l1 = GDN_L4(17, 1); const v4f l2 = GDN_L4(17, 2); const v4f l3 = GDN_L4(17, 3); const v4f l4 = GDN_L4(17, 4); __builtin_amdgcn_sched_barrier(0); x17 -= l0.x * x0; x17 -= l0.y * x1; x17 -= l0.z * x2; x17 -= l0.w * x3; x17 -= l1.x * x4; x17 -= l1.y * x5; x17 -= l1.z * x6; x17 -= l1.w * x7; x17 -= l2.x * x8; x17 -= l2.y * x9; x17 -= l2.z * x10; x17 -= l2.w * x11; x17 -= l3.x * x12; x17 -= l3.y * x13; x17 -= l3.z * x14; x17 -= l3.w * x15; x17 -= l4.x * x16; } __builtin_amdgcn_sched_barrier(0);
        float x18 = GDN_RHS(18); { const v4f l0 = GDN_L4(18, 0); const v4f l1 = GDN_L4(18, 1); const v4f l2 = GDN_L4(18, 2); const v4f l3 = GDN_L4(18, 3); const v4f l4 = GDN_L4(18, 4); __builtin_amdgcn_sched_barrier(0); x18 -= l0.x * x0; x18 -= l0.y * x1; x18 -= l0.z * x2; x18 -= l0.w * x3; x18 -= l1.x * x4; x18 -= l1.y * x5; x18 -= l1.z * x6; x18 -= l1.w * x7; x18 -= l2.x * x8; x18 -= l2.y * x9; x18 -= l2.z * x10; x18 -= l2.w * x11; x18 -= l3.x * x12; x18 -= l3.y * x13; x18 -= l3.z * x14; x18 -= l3.w * x15; x18 -= l4.x * x16; x18 -= l4.y * x17; } __builtin_amdgcn_sched_barrier(0);
        float x19 = GDN_RHS(19); { const v4f l0 = GDN_L4(19, 0); const v4f l1 = GDN_L4(19, 1); const v4f l2 = GDN_L4(19, 2); const v4f l3 = GDN_L4(19, 3); const v4f l4 = GDN_L4(19, 4); __builtin_amdgcn_sched_barrier(0); x19 -= l0.x * x0; x19 -= l0.y * x1; x19 -= l0.z * x2; x19 -= l0.w * x3; x19 -= l1.x * x4; x19 -= l1.y * x5; x19 -= l1.z * x6; x19 -= l1.w * x7; x19 -= l2.x * x8; x19 -= l2.y * x9; x19 -= l2.z * x10; x19 -= l2.w * x11; x19 -= l3.x * x12; x19 -= l3.y * x13; x19 -= l3.z * x14; x19 -= l3.w * x15; x19 -= l4.x * x16; x19 -= l4.y * x17; x19 -= l4.z * x18; } __builtin_amdgcn_sched_barrier(0);
        float x20 = GDN_RHS(20); { const v4f l0 = GDN_L4(20, 0); const v4f l1 = GDN_L4(20, 1); const v4f l2 = GDN_L4(20, 2); const v4f l3 = GDN_L4(20, 3); const v4f l4 = GDN_L4(20, 4); __builtin_amdgcn_sched_barrier(0); x20 -= l0.x * x0; x20 -= l0.y * x1; x20 -= l0.z * x2; x20 -= l0.w * x3; x20 -= l1.x * x4; x20 -= l1.y * x5; x20 -= l1.z * x6; x20 -= l1.w * x7; x20 -= l2.x * x8; x20 -= l2.y * x9; x20 -= l2.z * x10; x20 -= l2.w * x11; x20 -= l3.x * x12; x20 -= l3.y * x13; x20 -= l3.z * x14; x20 -= l3.w * x15; x20 -= l4.x * x16; x20 -= l4.y * x17; x20 -= l4.z * x18; x20 -= l4.w * x19; } __builtin_amdgcn_sched_barrier(0);
        float x21 = GDN_RHS(21); { const v4f l0 = GDN_L4(21, 0); const v4f l1 = GDN_L4(21, 1); const v4f l2 = GDN_L4(21, 2); const v4f l3 = GDN_L4(21, 3); const v4f l4 = GDN_L4(21, 4); const v4f l5 = GDN_L4(21, 5); __builtin_amdgcn_sched_barrier(0); x21 -= l0.x * x0; x21 -= l0.y * x1; x21 -= l0.z * x2; x21 -= l0.w * x3; x21 -= l1.x * x4; x21 -= l1.y * x5; x21 -= l1.z * x6; x21 -= l1.w * x7; x21 -= l2.x * x8; x21 -= l2.y * x9; x21 -= l2.z * x10; x21 -= l2.w * x11; x21 -= l3.x * x12; x21 -= l3.y * x13; x21 -= l3.z * x14; x21 -= l3.w * x15; x21 -= l4.x * x16; x21 -= l4.y * x17; x21 -= l4.z * x18; x21 -= l4.w * x19; x21 -= l5.x * x20; } __builtin_amdgcn_sched_barrier(0);
        float x22 = GDN_RHS(22); { const v4f l0 = GDN_L4(22, 0); const v4f l1 = GDN_L4(22, 1); const v4f l2 = GDN_L4(22, 2); const v4f l3 = GDN_L4(22, 3); const v4f l4 = GDN_L4(22, 4); const v4f l5 = GDN_L4(22, 5); __builtin_amdgcn_sched_barrier(0); x22 -= l0.x * x0; x22 -= l0.y * x1; x22 -= l0.z * x2; x22 -= l0.w * x3; x22 -= l1.x * x4; x22 -= l1.y * x5; x22 -= l1.z * x6; x22 -= l1.w * x7; x22 -= l2.x * x8; x22 -= l2.y * x9; x22 -= l2.z * x10; x22 -= l2.w * x11; x22 -= l3.x * x12; x22 -= l3.y * x13; x22 -= l3.z * x14; x22 -= l3.w * x15; x22 -= l4.x * x16; x22 -= l4.y * x17; x22 -= l4.z * x18; x22 -= l4.w * x19; x22 -= l5.x * x20; x22 -= l5.y * x21; } __builtin_amdgcn_sched_barrier(0);
        float x23 = GDN_RHS(23); { const v4f l0 = GDN_L4(23, 0); const v4f l1 = GDN_L4(23, 1); const v4f l2 = GDN_L4(23, 2); const v4f l3 = GDN_L4(23, 3); const v4f l4 = GDN_L4(23, 4); const v4f l5 = GDN_L4(23, 5); __builtin_amdgcn_sched_barrier(0); x23 -= l0.x * x0; x23 -= l0.y * x1; x23 -= l0.z * x2; x23 -= l0.w * x3; x23 -= l1.x * x4; x23 -= l1.y * x5; x23 -= l1.z * x6; x23 -= l1.w * x7; x23 -= l2.x * x8; x23 -= l2.y * x9; x23 -= l2.z * x10; x23 -= l2.w * x11; x23 -= l3.x * x12; x23 -= l3.y * x13; x23 -= l3.z * x14; x23 -= l3.w * x15; x23 -= l4.x * x16; x23 -= l4.y * x17; x23 -= l4.z * x18; x23 -= l4.w * x19; x23 -= l5.x * x20; x23 -= l5.y * x21; x23 -= l5.z * x22; } __builtin_amdgcn_sched_barrier(0);
        float x24 = GDN_RHS(24); { const v4f l0 = GDN_L4(24, 0); const v4f l1 = GDN_L4(24, 1); const v4f l2 = GDN_L4(24, 2); const v4f l3 = GDN_L4(24, 3); const v4f l4 = GDN_L4(24, 4); const v4f l5 = GDN_L4(24, 5); __builtin_amdgcn_sched_barrier(0); x24 -= l0.x * x0; x24 -= l0.y * x1; x24 -= l0.z * x2; x24 -= l0.w * x3; x24 -= l1.x * x4; x24 -= l1.y * x5; x24 -= l1.z * x6; x24 -= l1.w * x7; x24 -= l2.x * x8; x24 -= l2.y * x9; x24 -= l2.z * x10; x24 -= l2.w * x11; x24 -= l3.x * x12; x24 -= l3.y * x13; x24 -= l3.z * x14; x24 -= l3.w * x15; x24 -= l4.x * x16; x24 -= l4.y * x17; x24 -= l4.z * x18; x24 -= l4.w * x19; x24 -= l5.x * x20; x24 -= l5.y * x21; x24 -= l5.z * x22; x24 -= l5.w * x23; } __builtin_amdgcn_sched_barrier(0);
        float x25 = GDN_RHS(25); { const v4f l0 = GDN_L4(25, 0); const v4f l1 = GDN_L4(25, 1); const v4f l2 = GDN_L4(25, 2); const v4f l3 = GDN_L4(25, 3); const v4f l4 = GDN_L4(25, 4); const v4f l5 = GDN_L4(25, 5); const v4f l6 = GDN_L4(25, 6); __builtin_amdgcn_sched_barrier(0); x25 -= l0.x * x0; x25 -= l0.y * x1; x25 -= l0.z * x2; x25 -= l0.w * x3; x25 -= l1.x * x4; x25 -= l1.y * x5; x25 -= l1.z * x6; x25 -= l1.w * x7; x25 -= l2.x * x8; x25 -= l2.y * x9; x25 -= l2.z * x10; x25 -= l2.w * x11; x25 -= l3.x * x12; x25 -= l3.y * x13; x25 -= l3.z * x14; x25 -= l3.w * x15; x25 -= l4.x * x16; x25 -= l4.y * x17; x25 -= l4.z * x18; x25 -= l4.w * x19; x25 -= l5.x * x20; x25 -= l5.y * x21; x25 -= l5.z * x22; x25 -= l5.w * x23; x25 -= l6.x * x24; } __builtin_amdgcn_sched_barrier(0);
        float x26 = GDN_RHS(26); { const v4f l0 = GDN_L4(26, 0); const v4f l1 = GDN_L4(26, 1); const v4f l2 = GDN_L4(26, 2); const v4f l3 = GDN_L4(26, 3); const v4f l4 = GDN_L4(26, 4); const v4f l5 = GDN_L4(26, 5); const v4f l6 = GDN_L4(26, 6); __builtin_amdgcn_sched_barrier(0); x26 -= l0.x * x0; x26 -= l0.y * x1; x26 -= l0.z * x2; x26 -= l0.w * x3; x26 -= l1.x * x4; x26 -= l1.y * x5; x26 -= l1.z * x6; x26 -= l1.w * x7; x26 -= l2.x * x8; x26 -= l2.y * x9; x26 -= l2.z * x10; x26 -= l2.w * x11; x26 -= l3.x * x12; x26 -= l3.y * x13; x26 -= l3.z * x14; x26 -= l3.w * x15; x26 -= l4.x * x16; x26 -= l4.y * x17; x26 -= l4.z * x18; x26 -= l4.w * x19; x26 -= l5.x * x20; x26 -= l5.y * x21; x26 -= l5.z * x22; x26 -= l5.w * x23; x26 -= l6.x * x24; x26 -= l6.y * x25; } __builtin_amdgcn_sched_barrier(0);
        float x27 = GDN_RHS(27); { const v4f l0 = GDN_L4(27, 0); const v4f l1 = GDN_L4(27, 1); const v4f l2 = GDN_L4(27, 2); const v4f l3 = GDN_L4(27, 3); const v4f l4 = GDN_L4(27, 4); const v4f l5 = GDN_L4(27, 5); const v4f l6 = GDN_L4(27, 6); __builtin_amdgcn_sched_barrier(0); x27 -= l0.x * x0; x27 -= l0.y * x1; x27 -= l0.z * x2; x27 -= l0.w * x3; x27 -= l1.x * x4; x27 -= l1.y * x5; x27 -= l1.z * x6; x27 -= l1.w * x7; x27 -= l2.x * x8; x27 -= l2.y * x9; x27 -= l2.z * x10; x27 -= l2.w * x11; x27 -= l3.x * x12; x27 -= l3.y * x13; x27 -= l3.z * x14; x27 -= l3.w * x15; x27 -= l4.x * x16; x27 -= l4.y * x17; x27 -= l4.z * x18; x27 -= l4.w * x19; x27 -= l5.x * x20; x27 -= l5.y * x21; x27 -= l5.z * x22; x27 -= l5.w * x23; x27 -= l6.x * x24; x27 -= l6.y * x25; x27 -= l6.z * x26; } __builtin_amdgcn_sched_barrier(0);
        float x28 = GDN_RHS(28); { const v4f l0 = GDN_L4(28, 0); const v4f l1 = GDN_L4(28, 1); const v4f l2 = GDN_L4(28, 2); const v4f l3 = GDN_L4(28, 3); const v4f l4 = GDN_L4(28, 4); const v4f l5 = GDN_L4(28, 5); const v4f l6 = GDN_L4(28, 6); __builtin_amdgcn_sched_barrier(0); x28 -= l0.x * x0; x28 -= l0.y * x1; x28 -= l0.z * x2; x28 -= l0.w * x3; x28 -= l1.x * x4; x28 -= l1.y * x5; x28 -= l1.z * x6; x28 -= l1.w * x7; x28 -= l2.x * x8; x28 -= l2.y * x9; x28 -= l2.z * x10; x28 -= l2.w * x11; x28 -= l3.x * x12; x28 -= l3.y * x13; x28 -= l3.z * x14; x28 -= l3.w * x15; x28 -= l4.x * x16; x28 -= l4.y * x17; x28 -= l4.z * x18; x28 -= l4.w * x19; x28 -= l5.x * x20; x28 -= l5.y * x21; x28 -= l5.z * x22; x28 -= l5.w * x23; x28 -= l6.x * x24; x28 -= l6.y * x25; x28 -= l6.z * x26; x28 -= l6.w * x27; } __builtin_amdgcn_sched_barrier(0);
        float x29 = GDN_RHS(29); { const v4f l0 = GDN_L4(29, 0); const v4f l1 = GDN_L4(29, 1); const v4f l2 = GDN_L4(29, 2); const v4f l3 = GDN_L4(29, 3); const v4f l4 = GDN_L4(29, 4); const v4f l5 = GDN_L4(29, 5); const v4f l6 = GDN_L4(29, 6); const v4f l7 = GDN_L4(29, 7); __builtin_amdgcn_sched_barrier(0); x29 -= l0.x * x0; x29 -= l0.y * x1; x29 -= l0.z * x2; x29 -= l0.w * x3; x29 -= l1.x * x4; x29 -= l1.y * x5; x29 -= l1.z * x6; x29 -= l1.w * x7; x29 -= l2.x * x8; x29 -= l2.y * x9; x29 -= l2.z * x10; x29 -= l2.w * x11; x29 -= l3.x * x12; x29 -= l3.y * x13; x29 -= l3.z * x14; x29 -= l3.w * x15; x29 -= l4.x * x16; x29 -= l4.y * x17; x29 -= l4.z * x18; x29 -= l4.w * x19; x29 -= l5.x * x20; x29 -= l5.y * x21; x29 -= l5.z * x22; x29 -= l5.w * x23; x29 -= l6.x * x24; x29 -= l6.y * x25; x29 -= l6.z * x26; x29 -= l6.w * x27; x29 -= l7.x * x28; } __builtin_amdgcn_sched_barrier(0);
        float x30 = GDN_RHS(30); { const v4f l0 = GDN_L4(30, 0); const v4f l1 = GDN_L4(30, 1); const v4f l2 = GDN_L4(30, 2); const v4f l3 = GDN_L4(30, 3); const v4f l4 = GDN_L4(30, 4); const v4f l5 = GDN_L4(30, 5); const v4f l6 = GDN_L4(30, 6); const v4f l7 = GDN_L4(30, 7); __builtin_amdgcn_sched_barrier(0); x30 -= l0.x * x0; x30 -= l0.y * x1; x30 -= l0.z * x2; x30 -= l0.w * x3; x30 -= l1.x * x4; x30 -= l1.y * x5; x30 -= l1.z * x6; x30 -= l1.w * x7; x30 -= l2.x * x8; x30 -= l2.y * x9; x30 -= l2.z * x10; x30 -= l2.w * x11; x30 -= l3.x * x12; x30 -= l3.y * x13; x30 -= l3.z * x14; x30 -= l3.w * x15; x30 -= l4.x * x16; x30 -= l4.y * x17; x30 -= l4.z * x18; x30 -= l4.w * x19; x30 -= l5.x * x20; x30 -= l5.y * x21; x30 -= l5.z * x22; x30 -= l5.w * x23; x30 -= l6.x * x24; x30 -= l6.y * x25; x30 -= l6.z * x26; x30 -= l6.w * x27; x30 -= l7.x * x28; x30 -= l7.y * x29; } __builtin_amdgcn_sched_barrier(0);
        float x31 = GDN_RHS(31); { const v4f l0 = GDN_L4(31, 0); const v4f l1 = GDN_L4(31, 1); const v4f l2 = GDN_L4(31, 2); const v4f l3 = GDN_L4(31, 3); const v4f l4 = GDN_L4(31, 4); const v4f l5 = GDN_L4(31, 5); const v4f l6 = GDN_L4(31, 6); const v4f l7 = GDN_L4(31, 7); __builtin_amdgcn_sched_barrier(0); x31 -= l0.x * x0; x31 -= l0.y * x1; x31 -= l0.z * x2; x31 -= l0.w * x3; x31 -= l1.x * x4; x31 -= l1.y * x5; x31 -= l1.z * x6; x31 -= l1.w * x7; x31 -= l2.x * x8; x31 -= l2.y * x9; x31 -= l2.z * x10; x31 -= l2.w * x11; x31 -= l3.x * x12; x31 -= l3.y * x13; x31 -= l3.z * x14; x31 -= l3.w * x15; x31 -= l4.x * x16; x31 -= l4.y * x17; x31 -= l4.z * x18; x31 -= l4.w * x19; x31 -= l5.x * x20; x31 -= l5.y * x21; x31 -= l5.z * x22; x31 -= l5.w * x23; x31 -= l6.x * x24; x31 -= l6.y * x25; x31 -= l6.z * x26; x31 -= l6.w * x27; x31 -= l7.x * x28; x31 -= l7.y * x29; x31 -= l7.z * x30; } __builtin_amdgcn_sched_barrier(0);
        float x32 = GDN_RHS(32); { const v4f l0 = GDN_L4(32, 0); const v4f l1 = GDN_L4(32, 1); const v4f l2 = GDN_L4(32, 2); const v4f l3 = GDN_L4(32, 3); const v4f l4 = GDN_L4(32, 4); const v4f l5 = GDN_L4(32, 5); const v4f l6 = GDN_L4(32, 6); const v4f l7 = GDN_L4(32, 7); __builtin_amdgcn_sched_barrier(0); x32 -= l0.x * x0; x32 -= l0.y * x1; x32 -= l0.z * x2; x32 -= l0.w * x3; x32 -= l1.x * x4; x32 -= l1.y * x5; x32 -= l1.z * x6; x32 -= l1.w * x7; x32 -= l2.x * x8; x32 -= l2.y * x9; x32 -= l2.z * x10; x32 -= l2.w * x11; x32 -= l3.x * x12; x32 -= l3.y * x13; x32 -= l3.z * x14; x32 -= l3.w * x15; x32 -= l4.x * x16; x32 -= l4.y * x17; x32 -= l4.z * x18; x32 -= l4.w * x19; x32 -= l5.x * x20; x32 -= l5.y * x21; x32 -= l5.z * x22; x32 -= l5.w * x23; x32 -= l6.x * x24; x32 -= l6.y * x25; x32 -= l6.z * x26; x32 -= l6.w * x27; x32 -= l7.x * x28; x32 -= l7.y * x29; x32 -= l7.z * x30; x32 -= l7.w * x31; } __builtin_amdgcn_sched_barrier(0);
        float x33 = GDN_RHS(33); { const v4f l0 = GDN_L4(33, 0); const v4f l1 = GDN_L4(33, 1); const v4f l2 = GDN_L4(33, 2); const v4f l3 = GDN_L4(33, 3); const v4f l4 = GDN_L4(33, 4); const v4f l5 = GDN_L4(33, 5); const v4f l6 = GDN_L4(33, 6); const v4f l7 = GDN_L4(33, 7); __builtin_amdgcn_sched_barrier(0); x33 -= l0.x * x0; x33 -= l0.y * x1; x33 -= l0.z * x2; x33 -= l0.w * x3; x33 -= l1.x * x4; x33 -= l1.y * x5; x33 -= l1.z * x6; x33 -= l1.w * x7; x33 -= l2.x * x8; x33 -= l2.y * x9; x33 -= l2.z * x10; x33 -= l2.w * x11; x33 -= l3.x * x12; x33 -= l3.y * x13; x33 -= l3.z * x14; x33 -= l3.w * x15; x33 -= l4.x * x16; x33 -= l4.y * x17; x33 -= l4.z * x18; x33 -= l4.w * x19; x33 -= l5.x * x20; x33 -= l5.y * x21; x33 -= l5.z * x22; x33 -= l5.w * x23; x33 -= l6.x * x24; x33 -= l6.y * x25; x33 -= l6.z * x26; x33 -= l6.w * x27; x33 -= l7.x * x28; x33 -= l7.y * x29; x33 -= l7.z * x30; x33 -= l7.w * x31; } __builtin_amdgcn_sched_barrier(0); { const v4f l8 = GDN_L4(33, 8); __builtin_amdgcn_sched_barrier(0); x33 -= l8.x * x32; } __builtin_amdgcn_sched_barrier(0);
        float x34 = GDN_RHS(34); { const v4f l0 = GDN_L4(34, 0); const v4f l1 = GDN_L4(34, 1); const v4f l2 = GDN_L4(34, 2); const v4f l3 = GDN_L4(34, 3); const v4f l4 = GDN_L4(34, 4); const v4f l5 = GDN_L4(34, 5); const v4f l6 = GDN_L4(34, 6); const v4f l7 = GDN_L4(34, 7); __builtin_amdgcn_sched_barrier(0); x34 -= l0.x * x0; x34 -= l0.y * x1; x34 -= l0.z * x2; x34 -= l0.w * x3; x34 -= l1.x * x4; x34 -= l1.y * x5; x34 -= l1.z * x6; x34 -= l1.w * x7; x34 -= l2.x * x8; x34 -= l2.y * x9; x34 -= l2.z * x10; x34 -= l2.w * x11; x34 -= l3.x * x12; x34 -= l3.y * x13; x34 -= l3.z * x14; x34 -= l3.w * x15; x34 -= l4.x * x16; x34 -= l4.y * x17; x34 -= l4.z * x18; x34 -= l4.w * x19; x34 -= l5.x * x20; x34 -= l5.y * x21; x34 -= l5.z * x22; x34 -= l5.w * x23; x34 -= l6.x * x24; x34 -= l6.y * x25; x34 -= l6.z * x26; x34 -= l6.w * x27; x34 -= l7.x * x28; x34 -= l7.y * x29; x34 -= l7.z * x30; x34 -= l7.w * x31; } __builtin_amdgcn_sched_barrier(0); { const v4f l8 = GDN_L4(34, 8); __builtin_amdgcn_sched_barrier(0); x34 -= l8.x * x32; x34 -= l8.y * x33; } __builtin_amdgcn_sched_barrier(0);
        float x35 = GDN_RHS(35); { const v4f l0 = GDN_L4(35, 0); const v4f l1 = GDN_L4(35, 1); const v4f l2 = GDN_L4(35, 2); const v4f l3 = GDN_L4(35, 3); const v4f l4 = GDN_L4(35, 4); const v4f l5 = GDN_L4(35, 5); const v4f l6 = GDN_L4(35, 6); const v4f l7 = GDN_L4(35, 7); __builtin_amdgcn_sched_barrier(0); x35 -= l0.x * x0; x35 -= l0.y * x1; x35 -= l0.z * x2; x35 -= l0.w * x3; x35 -= l1.x * x4; x35 -= l1.y * x5; x35 -= l1.z * x6; x35 -= l1.w * x7; x35 -= l2.x * x8; x35 -= l2.y * x9; x35 -= l2.z * x10; x35 -= l2.w * x11; x35 -= l3.x * x12; x35 -= l3.y * x13; x35 -= l3.z * x14; x35 -= l3.w * x15; x35 -= l4.x * x16; x35 -= l4.y * x17; x35 -= l4.z * x18; x35 -= l4.w * x19; x35 -= l5.x * x20; x35 -= l5.y * x21; x35 -= l5.z * x22; x35 -= l5.w * x23; x35 -= l6.x * x24; x35 -= l6.y * x25; x35 -= l6.z * x26; x35 -= l6.w * x27; x35 -= l7.x * x28; x35 -= l7.y * x29; x35 -= l7.z * x30; x35 -= l7.w * x31; } __builtin_amdgcn_sched_barrier(0); { const v4f l8 = GDN_L4(35, 8); __builtin_amdgcn_sched_barrier(0); x35 -= l8.x * x32; x35 -= l8.y * x33; x35 -= l8.z * x34; } __builtin_amdgcn_sched_barrier(0);
        float x36 = GDN_RHS(36); { const v4f l0 = GDN_L4(36, 0); const v4f l1 = GDN_L4(36, 1); const v4f l2 = GDN_L4(36, 2); const v4f l3 = GDN_L4(36, 3); const v4f l4 = GDN_L4(36, 4); const v4f l5 = GDN_L4(36, 5); const v4f l6 = GDN_L4(36, 6); const v4f l7 = GDN_L4(36, 7); __builtin_amdgcn_sched_barrier(0); x36 -= l0.x * x0; x36 -= l0.y * x1; x36 -= l0.z * x2; x36 -= l0.w * x3; x36 -= l1.x * x4; x36 -= l1.y * x5; x36 -= l1.z * x6; x36 -= l1.w * x7; x36 -= l2.x * x8; x36 -= l2.y * x9; x36 -= l2.z * x10; x36 -= l2.w * x11; x36 -= l3.x * x12; x36 -= l3.y * x13; x36 -= l3.z * x14; x36 -= l3.w * x15; x36 -= l4.x * x16; x36 -= l4.y * x17; x36 -= l4.z * x18; x36 -= l4.w * x19; x36 -= l5.x * x20; x36 -= l5.y * x21; x36 -= l5.z * x22; x36 -= l5.w * x23; x36 -= l6.x * x24; x36 -= l6.y * x25; x36 -= l6.z * x26; x36 -= l6.w * x27; x36 -= l7.x * x28; x36 -= l7.y * x29; x36 -= l7.z * x30; x36 -= l7.w * x31; } __builtin_amdgcn_sched_barrier(0); { const v4f l8 = GDN_L4(36, 8); __builtin_amdgcn_sched_barrier(0); x36 -= l8.x * x32; x36 -= l8.y * x33; x36 -= l8.z * x34; x36 -= l8.w * x35; } __builtin_amdgcn_sched_barrier(0);
        float x37 = GDN_RHS(37); { const v4f l0 = GDN_L4(37, 0); const v4f l1 = GDN_L4(37, 1); const v4f l2 = GDN_L4(37, 2); const v4f l3 = GDN_L4(37, 3); const v4f l4 = GDN_L4(37, 4); const v4f l5 = GDN_L4(37, 5); const v4f l6 = GDN_L4(37, 6); const v4f l7 = GDN_L4(37, 7); __builtin_amdgcn_sched_barrier(0); x37 -= l0.x * x0; x37 -= l0.y * x1; x37 -= l0.z * x2; x37 -= l0.w * x3; x37 -= l1.x * x4; x37 -= l1.y * x5; x37 -= l1.z * x6; x37 -= l1.w * x7; x37 -= l2.x * x8; x37 -= l2.y * x9; x37 -= l2.z * x10; x37 -= l2.w * x11; x37 -= l3.x * x12; x37 -= l3.y * x13; x37 -= l3.z * x14; x37 -= l3.w * x15; x37 -= l4.x * x16; x37 -= l4.y * x17; x37 -= l4.z * x18; x37 -= l4.w * x19; x37 -= l5.x * x20; x37 -= l5.y * x21; x37 -= l5.z * x22; x37 -= l5.w * x23; x37 -= l6.x * x24; x37 -= l6.y * x25; x37 -= l6.z * x26; x37 -= l6.w * x27; x37 -= l7.x * x28; x37 -= l7.y * x29; x37 -= l7.z * x30; x37 -= l7.w * x31; } __builtin_amdgcn_sched_barrier(0); { const v4f l8 = GDN_L4(37, 8); const v4f l9 = GDN_L4(37, 9); __builtin_amdgcn_sched_barrier(0); x37 -= l8.x * x32; x37 -= l8.y * x33; x37 -= l8.z * x34; x37 -= l8.w * x35; x37 -= l9.x * x36; } __builtin_amdgcn_sched_barrier(0);
        float x38 = GDN_RHS(38); { const v4f l0 = GDN_L4(38, 0); const v4f l1 = GDN_L4(38, 1); const v4f l2 = GDN_L4(38, 2); const v4f l3 = GDN_L4(38, 3); const v4f l4 = GDN_L4(38, 4); const v4f l5 = GDN_L4(38, 5); const v4f l6 = GDN_L4(38, 6); const v4f l7 = GDN_L4(38, 7); __builtin_amdgcn_sched_barrier(0); x38 -= l0.x * x0; x38 -= l0.y * x1; x38 -= l0.z * x2; x38 -= l0.w * x3; x38 -= l1.x * x4; x38 -= l1.y * x5; x38 -= l1.z * x6; x38 -= l1.w * x7; x38 -= l2.x * x8; x38 -= l2.y * x9; x38 -= l2.z * x10; x38 -= l2.w * x11; x38 -= l3.x * x12; x38 -= l3.y * x13; x38 -= l3.z * x14; x38 -= l3.w * x15; x38 -= l4.x * x16; x38 -= l4.y * x17; x38 -= l4.z * x18; x38 -= l4.w * x19; x38 -= l5.x * x20; x38 -= l5.y * x21; x38 -= l5.z * x22; x38 -= l5.w * x23; x38 -= l6.x * x24; x38 -= l6.y * x25; x38 -= l6.z * x26; x38 -= l6.w * x27; x38 -= l7.x * x28; x38 -= l7.y * x29; x38 -= l7.z * x30; x38 -= l7.w * x31; } __builtin_amdgcn_sched_barrier(0); { const v4f l8 = GDN_L4(38, 8); const v4f l9 = GDN_L4(38, 9); __builtin_amdgcn_sched_barrier(0); x38 -= l8.x * x32; x38 -= l8.y * x33; x38 -= l8.z * x34; x38 -= l8.w * x35; x38 -= l9.x * x36; x38 -= l9.y * x37; } __builtin_amdgcn_sched_barrier(0);
        float x39 = GDN_RHS(39); { const v4f l0 = GDN_L4(39, 0); const v4f l1 = GDN_L4(39, 1); const v4f l2 = GDN_L4(39, 2); const v4f l3 = GDN_L4(39, 3); const v4f l4 = GDN_L4(39, 4); const v4f l5 = GDN_L4(39, 5); const v4f l6 = GDN_L4(39, 6); const v4f l7 = GDN_L4(39, 7); __builtin_amdgcn_sched_barrier(0); x39 -= l0.x * x0; x39 -= l0.y * x1; x39 -= l0.z * x2; x39 -= l0.w * x3; x39 -= l1.x * x4; x39 -= l1.y * x5; x39 -= l1.z * x6; x39 -= l1.w * x7; x39 -= l2.x * x8; x39 -= l2.y * x9; x39 -= l2.z * x10; x39 -= l2.w * x11; x39 -= l3.x * x12; x39 -= l3.y * x13; x39 -= l3.z * x14; x39 -= l3.w * x15; x39 -= l4.x * x16; x39 -= l4.y * x17; x39 -= l4.z * x18; x39 -= l4.w * x19; x39 -= l5.x * x20; x39 -= l5.y * x21; x39 -= l5.z * x22; x39 -= l5.w * x23; x39 -= l6.x * x24; x39 -= l6.y * x25; x39 -= l6.z * x26; x39 -= l6.w * x27; x39 -= l7.x * x28; x39 -= l7.y * x29; x39 -= l7.z * x30; x39 -= l7.w * x31; } __builtin_amdgcn_sched_barrier(0); { const v4f l8 = GDN_L4(39, 8); const v4f l9 = GDN_L4(39, 9); __builtin_amdgcn_sched_barrier(0); x39 -= l8.x * x32; x39 -= l8.y * x33; x39 -= l8.z * x34; x39 -= l8.w * x35; x39 -= l9.x * x36; x39 -= l9.y * x37; x39 -= l9.z * x38; } __builtin_amdgcn_sched_barrier(0);
        float x40 = GDN_RHS(40); { const v4f l0 = GDN_L4(40, 0); const v4f l1 = GDN_L4(40, 1); const v4f l2 = GDN_L4(40, 2); const v4f l3 = GDN_L4(40, 3); const v4f l4 = GDN_L4(40, 4); const v4f l5 = GDN_L4(40, 5); const v4f l6 = GDN_L4(40, 6); const v4f l7 = GDN_L4(40, 7); __builtin_amdgcn_sched_barrier(0); x40 -= l0.x * x0; x40 -= l0.y * x1; x40 -= l0.z * x2; x40 -= l0.w * x3; x40 -= l1.x * x4; x40 -= l1.y * x5; x40 -= l1.z * x6; x40 -= l1.w * x7; x40 -= l2.x * x8; x40 -= l2.y * x9; x40 -= l2.z * x10; x40 -= l2.w * x11; x40 -= l3.x * x12; x40 -= l3.y * x13; x40 -= l3.z * x14; x40 -= l3.w * x15; x40 -= l4.x * x16; x40 -= l4.y * x17; x40 -= l4.z * x18; x40 -= l4.w * x19; x40 -= l5.x * x20; x40 -= l5.y * x21; x40 -= l5.z * x22; x40 -= l5.w * x23; x40 -= l6.x * x24; x40 -= l6.y * x25; x40 -= l6.z * x26; x40 -= l6.w * x27; x40 -= l7.x * x28; x40 -= l7.y * x29; x40 -= l7.z * x30; x40 -= l7.w * x31; } __builtin_amdgcn_sched_barrier(0); { const v4f l8 = GDN_L4(40, 8); const v4f l9 = GDN_L4(40, 9); __builtin_amdgcn_sched_barrier(0); x40 -= l8.x * x32; x40 -= l8.y * x33; x40 -= l8.z * x34; x40 -= l8.w * x35; x40 -= l9.x * x36; x40 -= l9.y * x37; x40 -= l9.z * x38; x40 -= l9.w * x39; } __builtin_amdgcn_sched_barrier(0);
        float x41 = GDN_RHS(41); { const v4f l0 = GDN_L4(41, 0); const v4f l1 = GDN_L4(41, 1); const v4f l2 = GDN_L4(41, 2); const v4f l3 = GDN_L4(41, 3); const v4f l4 = GDN_L4(41, 4); const v4f l5 = GDN_L4(41, 5); const v4f l6 = GDN_L4(41, 6); const v4f l7 = GDN_L4(41, 7); __builtin_amdgcn_sched_barrier(0); x41 -= l0.x * x0; x41 -= l0.y * x1; x41 -= l0.z * x2; x41 -= l0.w * x3; x41 -= l1.x * x4; x41 -= l1.y * x5; x41 -= l1.z * x6; x41 -= l1.w * x7; x41 -= l2.x * x8; x41 -= l2.y * x9; x41 -= l2.z * x10; x41 -= l2.w * x11; x41 -= l3.x * x12; x41 -= l3.y * x13; x41 -= l3.z * x14; x41 -= l3.w * x15; x41 -= l4.x * x16; x41 -= l4.y * x17; x41 -= l4.z * x18; x41 -= l4.w * x19; x41 -= l5.x * x20; x41 -= l5.y * x21; x41 -= l5.z * x22; x41 -= l5.w * x23; x41 -= l6.x * x24; x41 -= l6.y * x25; x41 -= l6.z * x26; x41 -= l6.w * x27; x41 -= l7.x * x28; x41 -= l7.y * x29; x41 -= l7.z * x30; x41 -= l7.w * x31; } __builtin_amdgcn_sched_barrier(0); { const v4f l8 = GDN_L4(41, 8); const v4f l9 = GDN_L4(41, 9); const v4f l10 = GDN_L4(41, 10); __builtin_amdgcn_sched_barrier(0); x41 -= l8.x * x32; x41 -= l8.y * x33; x41 -= l8.z * x34; x41 -= l8.w * x35; x41 -= l9.x * x36; x41 -= l9.y * x37; x41 -= l9.z * x38; x41 -= l9.w * x39; x41 -= l10.x * x40; } __builtin_amdgcn_sched_barrier(0);
        float x42 = GDN_RHS(42); { const v4f l0 = GDN_L4(42, 0); const v4f l1 = GDN_L4(42, 1); const v4f l2 = GDN_L4(42, 2); const v4f l3 = GDN_L4(42, 3); const v4f l4 = GDN_L4(42, 4); const v4f l5 = GDN_L4(42, 5); const v4f l6 = GDN_L4(42, 6); const v4f l7 = GDN_L4(42, 7); __builtin_amdgcn_sched_barrier(0); x42 -= l0.x * x0; x42 -= l0.y * x1; x42 -= l0.z * x2; x42 -= l0.w * x3; x42 -= l1.x * x4; x42 -= l1.y * x5; x42 -= l1.z * x6; x42 -= l1.w * x7; x42 -= l2.x * x8; x42 -= l2.y * x9; x42 -= l2.z * x10; x42 -= l2.w * x11; x42 -= l3.x * x12; x42 -= l3.y * x13; x42 -= l3.z * x14; x42 -= l3.w * x15; x42 -= l4.x * x16; x42 -= l4.y * x17; x42 -= l4.z * x18; x42 -= l4.w * x19; x42 -= l5.x * x20; x42 -= l5.y * x21; x42 -= l5.z * x22; x42 -= l5.w * x23; x42 -= l6.x * x24; x42 -= l6.y * x25; x42 -= l6.z * x26; x42 -= l6.w * x27; x42 -= l7.x * x28; x42 -= l7.y * x29; x42 -= l7.z * x30; x42 -= l7.w * x31; } __builtin_amdgcn_sched_barrier(0); { const v4f l8 = GDN_L4(42, 8); const v4f l9 = GDN_L4(42, 9); const v4f l10 = GDN_L4(42, 10); __builtin_amdgcn_sched_barrier(0); x42 -= l8.x * x32; x42 -= l8.y * x33; x42 -= l8.z * x34; x42 -= l8.w * x35; x42 -= l9.x * x36; x42 -= l9.y * x37; x42 -= l9.z * x38; x42 -= l9.w * x39; x42 -= l10.x * x40; x42 -= l10.y * x41; } __builtin_amdgcn_sched_barrier(0);
        float x43 = GDN_RHS(43); { const v4f l0 = GDN_L4(43, 0); const v4f l1 = GDN_L4(43, 1); const v4f l2 = GDN_L4(43, 2); const v4f l3 = GDN_L4(43, 3); const v4f l4 = GDN_L4(43, 4); const v4f l5 = GDN_L4(43, 5); const v4f l6 = GDN_L4(43, 6); const v4f l7 = GDN_L4(43, 7); __builtin_amdgcn_sched_barrier(0); x43 -= l0.x * x0; x43 -= l0.y * x1; x43 -= l0.z * x2; x43 -= l0.w * x3; x43 -= l1.x * x4; x43 -= l1.y * x5; x43 -= l1.z * x6; x43 -= l1.w * x7; x43 -= l2.x * x8; x43 -= l2.y * x9; x43 -= l2.z * x10; x43 -= l2.w * x11; x43 -= l3.x * x12; x43 -= l3.y * x13; x43 -= l3.z * x14; x43 -= l3.w * x15; x43 -= l4.x * x16; x43 -= l4.y * x17; x43 -= l4.z * x18; x43 -= l4.w * x19; x43 -= l5.x * x20; x43 -= l5.y * x21; x43 -= l5.z * x22; x43 -= l5.w * x23; x43 -= l6.x * x24; x43 -= l6.y * x25; x43 -= l6.z * x26; x43 -= l6.w * x27; x43 -= l7.x * x28; x43 -= l7.y * x29; x43 -= l7.z * x30; x43 -= l7.w * x31; } __builtin_amdgcn_sched_barrier(0); { const v4f l8 = GDN_L4(43, 8); const v4f l9 = GDN_L4(43, 9); const v4f l10 = GDN_L4(43, 10); __builtin_amdgcn_sched_barrier(0); x43 -= l8.x * x32; x43 -= l8.y * x33; x43 -= l8.z * x34; x43 -= l8.w * x35; x43 -= l9.x * x36; x43 -= l9.y * x37; x43 -= l9.z * x38; x43 -= l9.w * x39; x43 -= l10.x * x40; x43 -= l10.y * x41; x43 -= l10.z * x42; } __builtin_amdgcn_sched_barrier(0);
        float x44 = GDN_RHS(44); { const v4f l0 = GDN_L4(44, 0); const v4f l1 = GDN_L4(44, 1); const v4f l2 = GDN_L4(44, 2); const v4f l3 = GDN_L4(44, 3); const v4f l4 = GDN_L4(44, 4); const v4f l5 = GDN_L4(44, 5); const v4f l6 = GDN_L4(44, 6); const v4f l7 = GDN_L4(44, 7); __builtin_amdgcn_sched_barrier(0); x44 -= l0.x * x0; x44 -= l0.y * x1; x44 -= l0.z * x2; x44 -= l0.w * x3; x44 -= l1.x * x4; x44 -= l1.y * x5; x44 -= l1.z * x6; x44 -= l1.w * x7; x44 -= l2.x * x8; x44 -= l2.y * x9; x44 -= l2.z * x10; x44 -= l2.w * x11; x44 -= l3.x * x12; x44 -= l3.y * x13; x44 -= l3.z * x14; x44 -= l3.w * x15; x44 -= l4.x * x16; x44 -= l4.y * x17; x44 -= l4.z * x18; x44 -= l4.w * x19; x44 -= l5.x * x20; x44 -= l5.y * x21; x44 -= l5.z * x22; x44 -= l5.w * x23; x44 -= l6.x * x24; x44 -= l6.y * x25; x44 -= l6.z * x26; x44 -= l6.w * x27; x44 -= l7.x * x28; x44 -= l7.y * x29; x44 -= l7.z * x30; x44 -= l7.w * x31; } __builtin_amdgcn_sched_barrier(0); { const v4f l8 = GDN_L4(44, 8); const v4f l9 = GDN_L4(44, 9); const v4f l10 = GDN_L4(44, 10); __builtin_amdgcn_sched_barrier(0); x44 -= l8.x * x32; x44 -= l8.y * x33; x44 -= l8.z * x34; x44 -= l8.w * x35; x44 -= l9.x * x36; x44 -= l9.y * x37; x44 -= l9.z * x38; x44 -= l9.w * x39; x44 -= l10.x * x40; x44 -= l10.y * x41; x44 -= l10.z * x42; x44 -= l10.w * x43; } __builtin_amdgcn_sched_barrier(0);
        float x45 = GDN_RHS(45); { const v4f l0 = GDN_L4(45, 0); const v4f l1 = GDN_L4(45, 1); const v4f l2 = GDN_L4(45, 2); const v4f l3 = GDN_L4(45, 3); const v4f l4 = GDN_L4(45, 4); const v4f l5 = GDN_L4(45, 5); const v4f l6 = GDN_L4(45, 6); const v4f l7 = GDN_L4(45, 7); __builtin_amdgcn_sched_barrier(0); x45 -= l0.x * x0; x45 -= l0.y * x1; x45 -= l0.z * x2; x45 -= l0.w * x3; x45 -= l1.x * x4; x45 -= l1.y * x5; x45 -= l1.z * x6; x45 -= l1.w * x7; x45 -= l2.x * x8; x45 -= l2.y * x9; x45 -= l2.z * x10; x45 -= l2.w * x11; x45 -= l3.x * x12; x45 -= l3.y * x13; x45 -= l3.z * x14; x45 -= l3.w * x15; x45 -= l4.x * x16; x45 -= l4.y * x17; x45 -= l4.z * x18; x45 -= l4.w * x19; x45 -= l5.x * x20; x45 -= l5.y * x21; x45 -= l5.z * x22; x45 -= l5.w * x23; x45 -= l6.x * x24; x45 -= l6.y * x25; x45 -= l6.z * x26; x45 -= l6.w * x27; x45 -= l7.x * x28; x45 -= l7.y * x29; x45 -= l7.z * x30; x45 -= l7.w * x31; } __builtin_amdgcn_sched_barrier(0); { const v4f l8 = GDN_L4(45, 8); const v4f l9 = GDN_L4(45, 9); const v4f l10 = GDN_L4(45, 10); const v4f l11 = GDN_L4(45, 11); __builtin_amdgcn_sched_barrier(0); x45 -= l8.x * x32; x45 -= l8.y * x33; x45 -= l8.z * x34; x45 -= l8.w * x35; x45 -= l9.x * x36; x45 -= l9.y * x37; x45 -= l9.z * x38; x45 -= l9.w * x39; x45 -= l10.x * x40; x45 -= l10.y * x41; x45 -= l10.z * x42; x45 -= l10.w * x43; x45 -= l11.x * x44; } __builtin_amdgcn_sched_barrier(0);
        float x46 = GDN_RHS(46); { const v4f l0 = GDN_L4(46, 0); const v4f l1 = GDN_L4(46, 1); const v4f l2 = GDN_L4(46, 2); const v4f l3 = GDN_L4(46, 3); const v4f l4 = GDN_L4(46, 4); const v4f l5 = GDN_L4(46, 5); const v4f l6 = GDN_L4(46, 6); const v4f l7 = GDN_L4(46, 7); __builtin_amdgcn_sched_barrier(0); x46 -= l0.x * x0; x46 -= l0.y * x1; x46 -= l0.z * x2; x46 -= l0.w * x3; x46 -= l1.x * x4; x46 -= l1.y * x5; x46 -= l1.z * x6; x46 -= l1.w * x7; x46 -= l2.x * x8; x46 -= l2.y * x9; x46 -= l2.z * x10; x46 -= l2.w * x11; x46 -= l3.x * x12; x46 -= l3.y * x13; x46 -= l3.z * x14; x46 -= l3.w * x15; x46 -= l4.x * x16; x46 -= l4.y * x17; x46 -= l4.z * x18; x46 -= l4.w * x19; x46 -= l5.x * x20; x46 -= l5.y * x21; x46 -= l5.z * x22; x46 -= l5.w * x23; x46 -= l6.x * x24; x46 -= l6.y * x25; x46 -= l6.z * x26; x46 -= l6.w * x27; x46 -= l7.x * x28; x46 -= l7.y * x29; x46 -= l7.z * x30; x46 -= l7.w * x31; } __builtin_amdgcn_sched_barrier(0); { const v4f l8 = GDN_L4(46, 8); const v4f l9 = GDN_L4(46, 9); const v4f l10 = GDN_L4(46, 10); const v4f l11 = GDN_L4(46, 11); __builtin_amdgcn_sched_barrier(0); x46 -= l8.x * x32; x46 -= l8.y * x33; x46 -= l8.z * x34; x46 -= l8.w * x35; x46 -= l9.x * x36; x46 -= l9.y * x37; x46 -= l9.z * x38; x46 -= l9.w * x39; x46 -= l10.x * x40; x46 -= l10.y * x41; x46 -= l10.z * x42; x46 -= l10.w * x43; x46 -= l11.x * x44; x46 -= l11.y * x45; } __builtin_amdgcn_sched_barrier(0);
        float x47 = GDN_RHS(47); { const v4f l0 = GDN_L4(47, 0); const v4f l1 = GDN_L4(47, 1); const v4f l2 = GDN_L4(47, 2); const v4f l3 = GDN_L4(47, 3); const v4f l4 = GDN_L4(47, 4); const v4f l5 = GDN_L4(47, 5); const v4f l6 = GDN_L4(47, 6); const v4f l7 = GDN_L4(47, 7); __builtin_amdgcn_sched_barrier(0); x47 -= l0.x * x0; x47 -= l0.y * x1; x47 -= l0.z * x2; x47 -= l0.w * x3; x47 -= l1.x * x4; x47 -= l1.y * x5; x47 -= l1.z * x6; x47 -= l1.w * x7; x47 -= l2.x * x8; x47 -= l2.y * x9; x47 -= l2.z * x10; x47 -= l2.w * x11; x47 -= l3.x * x12; x47 -= l3.y * x13; x47 -= l3.z * x14; x47 -= l3.w * x15; x47 -= l4.x * x16; x47 -= l4.y * x17; x47 -= l4.z * x18; x47 -= l4.w * x19; x47 -= l5.x * x20; x47 -= l5.y * x21; x47 -= l5.z * x22; x47 -= l5.w * x23; x47 -= l6.x * x24; x47 -= l6.y * x25; x47 -= l6.z * x26; x47 -= l6.w * x27; x47 -= l7.x * x28; x47 -= l7.y * x29; x47 -= l7.z * x30; x47 -= l7.w * x31; } __builtin_amdgcn_sched_barrier(0); { const v4f l8 = GDN_L4(47, 8); const v4f l9 = GDN_L4(47, 9); const v4f l10 = GDN_L4(47, 10); const v4f l11 = GDN_L4(47, 11); __builtin_amdgcn_sched_barrier(0); x47 -= l8.x * x32; x47 -= l8.y * x33; x47 -= l8.z * x34; x47 -= l8.w * x35; x47 -= l9.x * x36; x47 -= l9.y * x37; x47 -= l9.z * x38; x47 -= l9.w * x39; x47 -= l10.x * x40; x47 -= l10.y * x41; x47 -= l10.z * x42; x47 -= l10.w * x43; x47 -= l11.x * x44; x47 -= l11.y * x45; x47 -= l11.z * x46; } __builtin_amdgcn_sched_barrier(0);
        float x48 = GDN_RHS(48); { const v4f l0 = GDN_L4(48, 0); const v4f l1 = GDN_L4(48, 1); const v4f l2 = GDN_L4(48, 2); const v4f l3 = GDN_L4(48, 3); const v4f l4 = GDN_L4(48, 4); const v4f l5 = GDN_L4(48, 5); const v4f l6 = GDN_L4(48, 6); const v4f l7 = GDN_L4(48, 7); __builtin_amdgcn_sched_barrier(0); x48 -= l0.x * x0; x48 -= l0.y * x1; x48 -= l0.z * x2; x48 -= l0.w * x3; x48 -= l1.x * x4; x48 -= l1.y * x5; x48 -= l1.z * x6; x48 -= l1.w * x7; x48 -= l2.x * x8; x48 -= l2.y * x9; x48 -= l2.z * x10; x48 -= l2.w * x11; x48 -= l3.x * x12; x48 -= l3.y * x13; x48 -= l3.z * x14; x48 -= l3.w * x15; x48 -= l4.x * x16; x48 -= l4.y * x17; x48 -= l4.z * x18; x48 -= l4.w * x19; x48 -= l5.x * x20; x48 -= l5.y * x21; x48 -= l5.z * x22; x48 -= l5.w * x23; x48 -= l6.x * x24; x48 -= l6.y * x25; x48 -= l6.z * x26; x48 -= l6.w * x27; x48 -= l7.x * x28; x48 -= l7.y * x29; x48 -= l7.z * x30; x48 -= l7.w * x31; } __builtin_amdgcn_sched_barrier(0); { const v4f l8 = GDN_L4(48, 8); const v4f l9 = GDN_L4(48, 9); const v4f l10 = GDN_L4(48, 10); const v4f l11 = GDN_L4(48, 11); __builtin_amdgcn_sched_barrier(0); x48 -= l8.x * x32; x48 -= l8.y * x33; x48 -= l8.z * x34; x48 -= l8.w * x35; x48 -= l9.x * x36; x48 -= l9.y * x37; x48 -= l9.z * x38; x48 -= l9.w * x39; x48 -= l10.x * x40; x48 -= l10.y * x41; x48 -= l10.z * x42; x48 -= l10.w * x43; x48 -= l11.x * x44; x48 -= l11.y * x45; x48 -= l11.z * x46; x48 -= l11.w * x47; } __builtin_amdgcn_sched_barrier(0);
        float x49 = GDN_RHS(49); { const v4f l0 = GDN_L4(49, 0); const v4f l1 = GDN_L4(49, 1); const v4f l2 = GDN_L4(49, 2); const v4f l3 = GDN_L4(49, 3); const v4f l4 = GDN_L4(49, 4); const v4f l5 = GDN_L4(49, 5); const v4f l6 = GDN_L4(49, 6); const v4f l7 = GDN_L4(49, 7); __builtin_amdgcn_sched_barrier(0); x49 -= l0.x * x0; x49 -= l0.y * x1; x49 -= l0.z * x2; x49 -= l0.w * x3; x49 -= l1.x * x4; x49 -= l1.y * x5; x49 -= l1.z * x6; x49 -= l1.w * x7; x49 -= l2.x * x8; x49 -= l2.y * x9; x49 -= l2.z * x10; x49 -= l2.w * x11; x49 -= l3.x * x12; x49 -= l3.y * x13; x49 -= l3.z * x14; x49 -= l3.w * x15; x49 -= l4.x * x16; x49 -= l4.y * x17; x49 -= l4.z * x18; x49 -= l4.w * x19; x49 -= l5.x * x20; x49 -= l5.y * x21; x49 -= l5.z * x22; x49 -= l5.w * x23; x49 -= l6.x * x24; x49 -= l6.y * x25; x49 -= l6.z * x26; x49 -= l6.w * x27; x49 -= l7.x * x28; x49 -= l7.y * x29; x49 -= l7.z * x30; x49 -= l7.w * x31; } __builtin_amdgcn_sched_barrier(0); { const v4f l8 = GDN_L4(49, 8); const v4f l9 = GDN_L4(49, 9); const v4f l10 = GDN_L4(49, 10); const v4f l11 = GDN_L4(49, 11); const v4f l12 = GDN_L4(49, 12); __builtin_amdgcn_sched_barrier(0); x49 -= l8.x * x32; x49 -= l8.y * x33; x49 -= l8.z * x34; x49 -= l8.w * x35; x49 -= l9.x * x36; x49 -= l9.y * x37; x49 -= l9.z * x38; x49 -= l9.w * x39; x49 -= l10.x * x40; x49 -= l10.y * x41; x49 -= l10.z * x42; x49 -= l10.w * x43; x49 -= l11.x * x44; x49 -= l11.y * x45; x49 -= l11.z * x46; x49 -= l11.w * x47; x49 -= l12.x * x48; } __builtin_amdgcn_sched_barrier(0);
        float x50 = GDN_RHS(50); { const v4f l0 = GDN_L4(50, 0); const v4f l1 = GDN_L4(50, 1); const v4f l2 = GDN_L4(50, 2); const v4f l3 = GDN_L4(50, 3); const v4f l4 = GDN_L4(50, 4); const v4f l5 = GDN_L4(50, 5); const v4f l6 = GDN_L4(50, 6); const v4f l7 = GDN_L4(50, 7); __builtin_amdgcn_sched_barrier(0); x50 -= l0.x * x0; x50 -= l0.y * x1; x50 -= l0.z * x2; x50 -= l0.w * x3; x50 -= l1.x * x4; x50 -= l1.y * x5; x50 -= l1.z * x6; x50 -= l1.w * x7; x50 -= l2.x * x8; x50 -= l2.y * x9; x50 -= l2.z * x10; x50 -= l2.w * x11; x50 -= l3.x * x12; x50 -= l3.y * x13; x50 -= l3.z * x14; x50 -= l3.w * x15; x50 -= l4.x * x16; x50 -= l4.y * x17; x50 -= l4.z * x18; x50 -= l4.w * x19; x50 -= l5.x * x20; x50 -= l5.y * x21; x50 -= l5.z * x22; x50 -= l5.w * x23; x50 -= l6.x * x24; x50 -= l6.y * x25; x50 -= l6.z * x26; x50 -= l6.w * x27; x50 -= l7.x * x28; x50 -= l7.y * x29; x50 -= l7.z * x30; x50 -= l7.w * x31; } __builtin_amdgcn_sched_barrier(0); { const v4f l8 = GDN_L4(50, 8); const v4f l9 = GDN_L4(50, 9); const v4f l10 = GDN_L4(50, 10); const v4f l11 = GDN_L4(50, 11); const v4f l12 = GDN_L4(50, 12); __builtin_amdgcn_sched_barrier(0); x50 -= l8.x * x32; x50 -= l8.y * x33; x50 -= l8.z * x34; x50 -= l8.w * x35; x50 -= l9.x * x36; x50 -= l9.y * x37; x50 -= l9.z * x38; x50 -= l9.w * x39; x50 -= l10.x * x40; x50 -= l10.y * x41; x50 -= l10.z * x42; x50 -= l10.w * x43; x50 -= l11.x * x44; x50 -= l11.y * x45; x50 -= l11.z * x46; x50 -= l11.w * x47; x50 -= l12.x * x48; x50 -= l12.y * x49; } __builtin_amdgcn_sched_barrier(0);
        float x51 = GDN_RHS(51); { const v4f l0 = GDN_L4(51, 0); const v4f l1 = GDN_L4(51, 1); const v4f l2 = GDN_L4(51, 2); const v4f l3 = GDN_L4(51, 3); const v4f l4 = GDN_L4(51, 4); const v4f l5 = GDN_L4(51, 5); const v4f l6 = GDN_L4(51, 6); const v4f l7 = GDN_L4(51, 7); __builtin_amdgcn_sched_barrier(0); x51 -= l0.x * x0; x51 -= l0.y * x1; x51 -= l0.z * x2; x51 -= l0.w * x3; x51 -= l1.x * x4; x51 -= l1.y * x5; x51 -= l1.z * x6; x51 -= l1.w * x7; x51 -= l2.x * x8; x51 -= l2.y * x9; x51 -= l2.z * x10; x51 -= l2.w * x11; x51 -= l3.x * x12; x51 -= l3.y * x13; x51 -= l3.z * x14; x51 -= l3.w * x15; x51 -= l4.x * x16; x51 -= l4.y * x17; x51 -= l4.z * x18; x51 -= l4.w * x19; x51 -= l5.x * x20; x51 -= l5.y * x21; x51 -= l5.z * x22; x51 -= l5.w * x23; x51 -= l6.x * x24; x51 -= l6.y * x25; x51 -= l6.z * x26; x51 -= l6.w * x27; x51 -= l7.x * x28; x51 -= l7.y * x29; x51 -= l7.z * x30; x51 -= l7.w * x31; } __builtin_amdgcn_sched_barrier(0); { const v4f l8 = GDN_L4(51, 8); const v4f l9 = GDN_L4(51, 9); const v4f l10 = GDN_L4(51, 10); const v4f l11 = GDN_L4(51, 11); const v4f l12 = GDN_L4(51, 12); __builtin_amdgcn_sched_barrier(0); x51 -= l8.x * x32; x51 -= l8.y * x33; x51 -= l8.z * x34; x51 -= l8.w * x35; x51 -= l9.x * x36; x51 -= l9.y * x37; x51 -= l9.z * x38; x51 -= l9.w * x39; x51 -= l10.x * x40; x51 -= l10.y * x41; x51 -= l10.z * x42; x51 -= l10.w * x43; x51 -= l11.x * x44; x51 -= l11.y * x45; x51 -= l11.z * x46; x51 -= l11.w * x47; x51 -= l12.x * x48; x51 -= l12.y * x49; x51 -= l12.z * x50; } __builtin_amdgcn_sched_barrier(0);
        float x52 = GDN_RHS(52); { const v4f l0 = GDN_L4(52, 0); const v4f l1 = GDN_L4(52, 1); const v4f l2 = GDN_L4(52, 2); const v4f l3 = GDN_L4(52, 3); const v4f l4 = GDN_L4(52, 4); const v4f l5 = GDN_L4(52, 5); const v4f l6 = GDN_L4(52, 6); const v4f l7 = GDN_L4(52, 7); __builtin_amdgcn_sched_barrier(0); x52 -= l0.x * x0; x52 -= l0.y * x1; x52 -= l0.z * x2; x52 -= l0.w * x3; x52 -= l1.x * x4; x52 -= l1.y * x5; x52 -= l1.z * x6; x52 -= l1.w * x7; x52 -= l2.x * x8; x52 -= l2.y * x9; x52 -= l2.z * x10; x52 -= l2.w * x11; x52 -= l3.x * x12; x52 -= l3.y * x13; x52 -= l3.z * x14; x52 -= l3.w * x15; x52 -= l4.x * x16; x52 -= l4.y * x17; x52 -= l4.z * x18; x52 -= l4.w * x19; x52 -= l5.x * x20; x52 -= l5.y * x21; x52 -= l5.z * x22; x52 -= l5.w * x23; x52 -= l6.x * x24; x52 -= l6.y * x25; x52 -= l6.z * x26; x52 -= l6.w * x27; x52 -= l7.x * x28; x52 -= l7.y * x29; x52 -= l7.z * x30; x52 -= l7.w * x31; } __builtin_amdgcn_sched_barrier(0); { const v4f l8 = GDN_L4(52, 8); const v4f l9 = GDN_L4(52, 9); const v4f l10 = GDN_L4(52, 10); const v4f l11 = GDN_L4(52, 11); const v4f l12 = GDN_L4(52, 12); __builtin_amdgcn_sched_barrier(0); x52 -= l8.x * x32; x52 -= l8.y * x33; x52 -= l8.z * x34; x52 -= l8.w * x35; x52 -= l9.x * x36; x52 -= l9.y * x37; x52 -= l9.z * x38; x52 -= l9.w * x39; x52 -= l10.x * x40; x52 -= l10.y * x41; x52 -= l10.z * x42; x52 -= l10.w * x43; x52 -= l11.x * x44; x52 -= l11.y * x45; x52 -= l11.z * x46; x52 -= l11.w * x47; x52 -= l12.x * x48; x52 -= l12.y * x49; x52 -= l12.z * x50; x52 -= l12.w * x51; } __builtin_amdgcn_sched_barrier(0);
        float x53 = GDN_RHS(53); { const v4f l0 = GDN_L4(53, 0); const v4f l1 = GDN_L4(53, 1); const v4f l2 = GDN_L4(53, 2); const v4f l3 = GDN_L4(53, 3); const v4f l4 = GDN_L4(53, 4); const v4f l5 = GDN_L4(53, 5); const v4f l6 = GDN_L4(53, 6); const v4f l7 = GDN_L4(53, 7); __builtin_amdgcn_sched_barrier(0); x53 -= l0.x * x0; x53 -= l0.y * x1; x53 -= l0.z * x2; x53 -= l0.w * x3; x53 -= l1.x * x4; x53 -= l1.y * x5; x53 -= l1.z * x6; x53 -= l1.w * x7; x53 -= l2.x * x8; x53 -= l2.y * x9; x53 -= l2.z * x10; x53 -= l2.w * x11; x53 -= l3.x * x12; x53 -= l3.y * x13; x53 -= l3.z * x14; x53 -= l3.w * x15; x53 -= l4.x * x16; x53 -= l4.y * x17; x53 -= l4.z * x18; x53 -= l4.w * x19; x53 -= l5.x * x20; x53 -= l5.y * x21; x53 -= l5.z * x22; x53 -= l5.w * x23; x53 -= l6.x * x24; x53 -= l6.y * x25; x53 -= l6.z * x26; x53 -= l6.w * x27; x53 -= l7.x * x28; x53 -= l7.y * x29; x53 -= l7.z * x30; x53 -= l7.w * x31; } __builtin_amdgcn_sched_barrier(0); { const v4f l8 = GDN_L4(53, 8); const v4f l9 = GDN_L4(53, 9); const v4f l10 = GDN_L4(53, 10); const v4f l11 = GDN_L4(53, 11); const v4f l12 = GDN_L4(53, 12); const v4f l13 = GDN_L4(53, 13); __builtin_amdgcn_sched_barrier(0); x53 -= l8.x * x32; x53 -= l8.y * x33; x53 -= l8.z * x34; x53 -= l8.w * x35; x53 -= l9.x * x36; x53 -= l9.y * x37; x53 -= l9.z * x38; x53 -= l9.w * x39; x53 -= l10.x * x40; x53 -= l10.y * x41; x53 -= l10.z * x42; x53 -= l10.w * x43; x53 -= l11.x * x44; x53 -= l11.y * x45; x53 -= l11.z * x46; x53 -= l11.w * x47; x53 -= l12.x * x48; x53 -= l12.y * x49; x53 -= l12.z * x50; x53 -= l12.w * x51; x53 -= l13.x * x52; } __builtin_amdgcn_sched_barrier(0);
        float x54 = GDN_RHS(54); { const v4f l0 = GDN_L4(54, 0); const v4f l1 = GDN_L4(54, 1); const v4f l2 = GDN_L4(54, 2); const v4f l3 = GDN_L4(54, 3); const v4f l4 = GDN_L4(54, 4); const v4f l5 = GDN_L4(54, 5); const v4f l6 = GDN_L4(54, 6); const v4f l7 = GDN_L4(54, 7); __builtin_amdgcn_sched_barrier(0); x54 -= l0.x * x0; x54 -= l0.y * x1; x54 -= l0.z * x2; x54 -= l0.w * x3; x54 -= l1.x * x4; x54 -= l1.y * x5; x54 -= l1.z * x6; x54 -= l1.w * x7; x54 -= l2.x * x8; x54 -= l2.y * x9; x54 -= l2.z * x10; x54 -= l2.w * x11; x54 -= l3.x * x12; x54 -= l3.y * x13; x54 -= l3.z * x14; x54 -= l3.w * x15; x54 -= l4.x * x16; x54 -= l4.y * x17; x54 -= l4.z * x18; x54 -= l4.w * x19; x54 -= l5.x * x20; x54 -= l5.y * x21; x54 -= l5.z * x22; x54 -= l5.w * x23; x54 -= l6.x * x24; x54 -= l6.y * x25; x54 -= l6.z * x26; x54 -= l6.w * x27; x54 -= l7.x * x28; x54 -= l7.y * x29; x54 -= l7.z * x30; x54 -= l7.w * x31; } __builtin_amdgcn_sched_barrier(0); { const v4f l8 = GDN_L4(54, 8); const v4f l9 = GDN_L4(54, 9); const v4f l10 = GDN_L4(54, 10); const v4f l11 = GDN_L4(54, 11); const v4f l12 = GDN_L4(54, 12); const v4f l13 = GDN_L4(54, 13); __builtin_amdgcn_sched_barrier(0); x54 -= l8.x * x32; x54 -= l8.y * x33; x54 -= l8.z * x34; x54 -= l8.w * x35; x54 -= l9.x * x36; x54 -= l9.y * x37; x54 -= l9.z * x38; x54 -= l9.w * x39; x54 -= l10.x * x40; x54 -= l10.y * x41; x54 -= l10.z * x42; x54 -= l10.w * x43; x54 -= l11.x * x44; x54 -= l11.y * x45; x54 -= l11.z * x46; x54 -= l11.w * x47; x54 -= l12.x * x48; x54 -= l12.y * x49; x54 -= l12.z * x50; x54 -= l12.w * x51; x54 -= l13.x * x52; x54 -= l13.y * x53; } __builtin_amdgcn_sched_barrier(0);
        float x55 = GDN_RHS(55); { const v4f l0 = GDN_L4(55, 0); const v4f l1 = GDN_L4(55, 1); const v4f l2 = GDN_L4(55, 2); const v4f l3 = GDN_L4(55, 3); const v4f l4 = GDN_L4(55, 4); const v4f l5 = GDN_L4(55, 5); const v4f l6 = GDN_L4(55, 6); const v4f l7 = GDN_L4(55, 7); __builtin_amdgcn_sched_barrier(0); x55 -= l0.x * x0; x55 -= l0.y * x1; x55 -= l0.z * x2; x55 -= l0.w * x3; x55 -= l1.x * x4; x55 -= l1.y * x5; x55 -= l1.z * x6; x55 -= l1.w * x7; x55 -= l2.x * x8; x55 -= l2.y * x9; x55 -= l2.z * x10; x55 -= l2.w * x11; x55 -= l3.x * x12; x55 -= l3.y * x13; x55 -= l3.z * x14; x55 -= l3.w * x15; x55 -= l4.x * x16; x55 -= l4.y * x17; x55 -= l4.z * x18; x55 -= l4.w * x19; x55 -= l5.x * x20; x55 -= l5.y * x21; x55 -= l5.z * x22; x55 -= l5.w * x23; x55 -= l6.x * x24; x55 -= l6.y * x25; x55 -= l6.z * x26; x55 -= l6.w * x27; x55 -= l7.x * x28; x55 -= l7.y * x29; x55 -= l7.z * x30; x55 -= l7.w * x31; } __builtin_amdgcn_sched_barrier(0); { const v4f l8 = GDN_L4(55, 8); const v4f l9 = GDN_L4(55, 9); const v4f l10 = GDN_L4(55, 10); const v4f l11 = GDN_L4(55, 11); const v4f l12 = GDN_L4(55, 12); const v4f l13 = GDN_L4(55, 13); __builtin_amdgcn_sched_barrier(0); x55 -= l8.x * x32; x55 -= l8.y * x33; x55 -= l8.z * x34; x55 -= l8.w * x35; x55 -= l9.x * x36; x55 -= l9.y * x37; x55 -= l9.z * x38; x55 -= l9.w * x39; x55 -= l10.x * x40; x55 -= l10.y * x41; x55 -= l10.z * x42; x55 -= l10.w * x43; x55 -= l11.x * x44; x55 -= l11.y * x45; x55 -= l11.z * x46; x55 -= l11.w * x47; x55 -= l12.x * x48; x55 -= l12.y * x49; x55 -= l12.z * x50; x55 -= l12.w * x51; x55 -= l13.x * x52; x55 -= l13.y * x53; x55 -= l13.z * x54; } __builtin_amdgcn_sched_barrier(0);
        float x56 = GDN_RHS(56); { const v4f l0 = GDN_L4(56, 0); const v4f l1 = GDN_L4(56, 1); const v4f l2 = GDN_L4(56, 2); const v4f l3 = GDN_L4(56, 3); const v4f l4 = GDN_L4(56, 4); const v4f l5 = GDN_L4(56, 5); const v4f l6 = GDN_L4(56, 6); const v4f l7 = GDN_L4(56, 7); __builtin_amdgcn_sched_barrier(0); x56 -= l0.x * x0; x56 -= l0.y * x1; x56 -= l0.z * x2; x56 -= l0.w * x3; x56 -= l1.x * x4; x56 -= l1.y * x5; x56 -= l1.z * x6; x56 -= l1.w * x7; x56 -= l2.x * x8; x56 -= l2.y * x9; x56 -= l2.z * x10; x56 -= l2.w * x11; x56 -= l3.x * x12; x56 -= l3.y * x13; x56 -= l3.z * x14; x56 -= l3.w * x15; x56 -= l4.x * x16; x56 -= l4.y * x17; x56 -= l4.z * x18; x56 -= l4.w * x19; x56 -= l5.x * x20; x56 -= l5.y * x21; x56 -= l5.z * x22; x56 -= l5.w * x23; x56 -= l6.x * x24; x56 -= l6.y * x25; x56 -= l6.z * x26; x56 -= l6.w * x27; x56 -= l7.x * x28; x56 -= l7.y * x29; x56 -= l7.z * x30; x56 -= l7.w * x31; } __builtin_amdgcn_sched_barrier(0); { const v4f l8 = GDN_L4(56, 8); const v4f l9 = GDN_L4(56, 9); const v4f l10 = GDN_L4(56, 10); const v4f l11 = GDN_L4(56, 11); const v4f l12 = GDN_L4(56, 12); const v4f l13 = GDN_L4(56, 13); __builtin_amdgcn_sched_barrier(0); x56 -= l8.x * x32; x56 -= l8.y * x33; x56 -= l8.z * x34; x56 -= l8.w * x35; x56 -= l9.x * x36; x56 -= l9.y * x37; x56 -= l9.z * x38; x56 -= l9.w * x39; x56 -= l10.x * x40; x56 -= l10.y * x41; x56 -= l10.z * x42; x56 -= l10.w * x43; x56 -= l11.x * x44; x56 -= l11.y * x45; x56 -= l11.z * x46; x56 -= l11.w * x47; x56 -= l12.x * x48; x56 -= l12.y * x49; x56 -= l12.z * x50; x56 -= l12.w * x51; x56 -= l13.x * x52; x56 -= l13.y * x53; x56 -= l13.z * x54; x56 -= l13.w * x55; } __builtin_amdgcn_sched_barrier(0);
        float x57 = GDN_RHS(57); { const v4f l0 = GDN_L4(57, 0); const v4f l1 = GDN_L4(57, 1); const v4f l2 = GDN_L4(57, 2); const v4f l3 = GDN_L4(57, 3); const v4f l4 = GDN_L4(57, 4); const v4f l5 = GDN_L4(57, 5); const v4f l6 = GDN_L4(57, 6); const v4f l7 = GDN_L4(57, 7); __builtin_amdgcn_sched_barrier(0); x57 -= l0.x * x0; x57 -= l0.y * x1; x57 -= l0.z * x2; x57 -= l0.w * x3; x57 -= l1.x * x4; x57 -= l1.y * x5; x57 -= l1.z * x6; x57 -= l1.w * x7; x57 -= l2.x * x8; x57 -= l2.y * x9; x57 -= l2.z * x10; x57 -= l2.w * x11; x57 -= l3.x * x12; x57 -= l3.y * x13; x57 -= l3.z * x14; x57 -= l3.w * x15; x57 -= l4.x * x16; x57 -= l4.y * x17; x57 -= l4.z * x18; x57 -= l4.w * x19; x57 -= l5.x * x20; x57 -= l5.y * x21; x57 -= l5.z * x22; x57 -= l5.w * x23; x57 -= l6.x * x24; x57 -= l6.y * x25; x57 -= l6.z * x26; x57 -= l6.w * x27; x57 -= l7.x * x28; x57 -= l7.y * x29; x57 -= l7.z * x30; x57 -= l7.w * x31; } __builtin_amdgcn_sched_barrier(0); { const v4f l8 = GDN_L4(57, 8); const v4f l9 = GDN_L4(57, 9); const v4f l10 = GDN_L4(57, 10); const v4f l11 = GDN_L4(57, 11); const v4f l12 = GDN_L4(57, 12); const v4f l13 = GDN_L4(57, 13); const v4f l14 = GDN_L4(57, 14); __builtin_amdgcn_sched_barrier(0); x57 -= l8.x * x32; x57 -= l8.y * x33; x57 -= l8.z * x34; x57 -= l8.w * x35; x57 -= l9.x * x36; x57 -= l9.y * x37; x57 -= l9.z * x38; x57 -= l9.w * x39; x57 -= l10.x * x40; x57 -= l10.y * x41; x57 -= l10.z * x42; x57 -= l10.w * x43; x57 -= l11.x * x44; x57 -= l11.y * x45; x57 -= l11.z * x46; x57 -= l11.w * x47; x57 -= l12.x * x48; x57 -= l12.y * x49; x57 -= l12.z * x50; x57 -= l12.w * x51; x57 -= l13.x * x52; x57 -= l13.y * x53; x57 -= l13.z * x54; x57 -= l13.w * x55; x57 -= l14.x * x56; } __builtin_amdgcn_sched_barrier(0);
        float x58 = GDN_RHS(58); { const v4f l0 = GDN_L4(58, 0); const v4f l1 = GDN_L4(58, 1); const v4f l2 = GDN_L4(58, 2); const v4f l3 = GDN_L4(58, 3); const v4f l4 = GDN_L4(58, 4); const v4f l5 = GDN_L4(58, 5); const v4f l6 = GDN_L4(58, 6); const v4f l7 = GDN_L4(58, 7); __builtin_amdgcn_sched_barrier(0); x58 -= l0.x * x0; x58 -= l0.y * x1; x58 -= l0.z * x2; x58 -= l0.w * x3; x58 -= l1.x * x4; x58 -= l1.y * x5; x58 -= l1.z * x6; x58 -= l1.w * x7; x58 -= l2.x * x8; x58 -= l2.y * x9; x58 -= l2.z * x10; x58 -= l2.w * x11; x58 -= l3.x * x12; x58 -= l3.y * x13; x58 -= l3.z * x14; x58 -= l3.w * x15; x58 -= l4.x * x16; x58 -= l4.y * x17; x58 -= l4.z * x18; x58 -= l4.w * x19; x58 -= l5.x * x20; x58 -= l5.y * x21; x58 -= l5.z * x22; x58 -= l5.w * x23; x58 -= l6.x * x24; x58 -= l6.y * x25; x58 -= l6.z * x26; x58 -= l6.w * x27; x58 -= l7.x * x28; x58 -= l7.y * x29; x58 -= l7.z * x30; x58 -= l7.w * x31; } __builtin_amdgcn_sched_barrier(0); { const v4f l8 = GDN_L4(58, 8); const v4f l9 = GDN_L4(58, 9); const v4f l10 = GDN_L4(58, 10); const v4f l11 = GDN_L4(58, 11); const v4f l12 = GDN_L4(58, 12); const v4f l13 = GDN_L4(58, 13); const v4f l14 = GDN_L4(58, 14); __builtin_amdgcn_sched_barrier(0); x58 -= l8.x * x32; x58 -= l8.y * x33; x58 -= l8.z * x34; x58 -= l8.w * x35; x58 -= l9.x * x36; x58 -= l9.y * x37; x58 -= l9.z * x38; x58 -= l9.w * x39; x58 -= l10.x * x40; x58 -= l10.y * x41; x58 -= l10.z * x42; x58 -= l10.w * x43; x58 -= l11.x * x44; x58 -= l11.y * x45; x58 -= l11.z * x46; x58 -= l11.w * x47; x58 -= l12.x * x48; x58 -= l12.y * x49; x58 -= l12.z * x50; x58 -= l12.w * x51; x58 -= l13.x * x52; x58 -= l13.y * x53; x58 -= l13.z * x54; x58 -= l13.w * x55; x58 -= l14.x * x56; x58 -= l14.y * x57; } __builtin_amdgcn_sched_barrier(0);
        float x59 = GDN_RHS(59); { const v4f l0 = GDN_L4(59, 0); const v4f l1 = GDN_L4(59, 1); const v4f l2 = GDN_L4(59, 2); const v4f l3 = GDN_L4(59, 3); const v4f l4 = GDN_L4(59, 4); const v4f l5 = GDN_L4(59, 5); const v4f l6 = GDN_L4(59, 6); const v4f l7 = GDN_L4(59, 7); __builtin_amdgcn_sched_barrier(0); x59 -= l0.x * x0; x59 -= l0.y * x1; x59 -= l0.z * x2; x59 -= l0.w * x3; x59 -= l1.x * x4; x59 -= l1.y * x5; x59 -= l1.z * x6; x59 -= l1.w * x7; x59 -= l2.x * x8; x59 -= l2.y * x9; x59 -= l2.z * x10; x59 -= l2.w * x11; x59 -= l3.x * x12; x59 -= l3.y * x13; x59 -= l3.z * x14; x59 -= l3.w * x15; x59 -= l4.x * x16; x59 -= l4.y * x17; x59 -= l4.z * x18; x59 -= l4.w * x19; x59 -= l5.x * x20; x59 -= l5.y * x21; x59 -= l5.z * x22; x59 -= l5.w * x23; x59 -= l6.x * x24; x59 -= l6.y * x25; x59 -= l6.z * x26; x59 -= l6.w * x27; x59 -= l7.x * x28; x59 -= l7.y * x29; x59 -= l7.z * x30; x59 -= l7.w * x31; } __builtin_amdgcn_sched_barrier(0); { const v4f l8 = GDN_L4(59, 8); const v4f l9 = GDN_L4(59, 9); const v4f l10 = GDN_L4(59, 10); const v4f l11 = GDN_L4(59, 11); const v4f l12 = GDN_L4(59, 12); const v4f l13 = GDN_L4(59, 13); const v4f l14 = GDN_L4(59, 14); __builtin_amdgcn_sched_barrier(0); x59 -= l8.x * x32; x59 -= l8.y * x33; x59 -= l8.z * x34; x59 -= l8.w * x35; x59 -= l9.x * x36; x59 -= l9.y * x37; x59 -= l9.z * x38; x59 -= l9.w * x39; x59 -= l10.x * x40; x59 -= l10.y * x41; x59 -= l10.z * x42; x59 -= l10.w * x43; x59 -= l11.x * x44; x59 -= l11.y * x45; x59 -= l11.z * x46; x59 -= l11.w * x47; x59 -= l12.x * x48; x59 -= l12.y * x49; x59 -= l12.z * x50; x59 -= l12.w * x51; x59 -= l13.x * x52; x59 -= l13.y * x53; x59 -= l13.z * x54; x59 -= l13.w * x55; x59 -= l14.x * x56; x59 -= l14.y * x57; x59 -= l14.z * x58; } __builtin_amdgcn_sched_barrier(0);
        float x60 = GDN_RHS(60); { const v4f l0 = GDN_L4(60, 0); const v4f l1 = GDN_L4(60, 1); const v4f l2 = GDN_L4(60, 2); const v4f l3 = GDN_L4(60, 3); const v4f l4 = GDN_L4(60, 4); const v4f l5 = GDN_L4(60, 5); const v4f l6 = GDN_L4(60, 6); const v4f l7 = GDN_L4(60, 7); __builtin_amdgcn_sched_barrier(0); x60 -= l0.x * x0; x60 -= l0.y * x1; x60 -= l0.z * x2; x60 -= l0.w * x3; x60 -= l1.x * x4; x60 -= l1.y * x5; x60 -= l1.z * x6; x60 -= l1.w * x7; x60 -= l2.x * x8; x60 -= l2.y * x9; x60 -= l2.z * x10; x60 -= l2.w * x11; x60 -= l3.x * x12; x60 -= l3.y * x13; x60 -= l3.z * x14; x60 -= l3.w * x15; x60 -= l4.x * x16; x60 -= l4.y * x17; x60 -= l4.z * x18; x60 -= l4.w * x19; x60 -= l5.x * x20; x60 -= l5.y * x21; x60 -= l5.z * x22; x60 -= l5.w * x23; x60 -= l6.x * x24; x60 -= l6.y * x25; x60 -= l6.z * x26; x60 -= l6.w * x27; x60 -= l7.x * x28; x60 -= l7.y * x29; x60 -= l7.z * x30; x60 -= l7.w * x31; } __builtin_amdgcn_sched_barrier(0); { const v4f l8 = GDN_L4(60, 8); const v4f l9 = GDN_L4(60, 9); const v4f l10 = GDN_L4(60, 10); const v4f l11 = GDN_L4(60, 11); const v4f l12 = GDN_L4(60, 12); const v4f l13 = GDN_L4(60, 13); const v4f l14 = GDN_L4(60, 14); __builtin_amdgcn_sched_barrier(0); x60 -= l8.x * x32; x60 -= l8.y * x33; x60 -= l8.z * x34; x60 -= l8.w * x35; x60 -= l9.x * x36; x60 -= l9.y * x37; x60 -= l9.z * x38; x60 -= l9.w * x39; x60 -= l10.x * x40; x60 -= l10.y * x41; x60 -= l10.z * x42; x60 -= l10.w * x43; x60 -= l11.x * x44; x60 -= l11.y * x45; x60 -= l11.z * x46; x60 -= l11.w * x47; x60 -= l12.x * x48; x60 -= l12.y * x49; x60 -= l12.z * x50; x60 -= l12.w * x51; x60 -= l13.x * x52; x60 -= l13.y * x53; x60 -= l13.z * x54; x60 -= l13.w * x55; x60 -= l14.x * x56; x60 -= l14.y * x57; x60 -= l14.z * x58; x60 -= l14.w * x59; } __builtin_amdgcn_sched_barrier(0);
        float x61 = GDN_RHS(61); { const v4f l0 = GDN_L4(61, 0); const v4f l1 = GDN_L4(61, 1); const v4f l2 = GDN_L4(61, 2); const v4f l3 = GDN_L4(61, 3); const v4f l4 = GDN_L4(61, 4); const v4f l5 = GDN_L4(61, 5); const v4f l6 = GDN_L4(61, 6); const v4f l7 = GDN_L4(61, 7); __builtin_amdgcn_sched_barrier(0); x61 -= l0.x * x0; x61 -= l0.y * x1; x61 -= l0.z * x2; x61 -= l0.w * x3; x61 -= l1.x * x4; x61 -= l1.y * x5; x61 -= l1.z * x6; x61 -= l1.w * x7; x61 -= l2.x * x8; x61 -= l2.y * x9; x61 -= l2.z * x10; x61 -= l2.w * x11; x61 -= l3.x * x12; x61 -= l3.y * x13; x61 -= l3.z * x14; x61 -= l3.w * x15; x61 -= l4.x * x16; x61 -= l4.y * x17; x61 -= l4.z * x18; x61 -= l4.w * x19; x61 -= l5.x * x20; x61 -= l5.y * x21; x61 -= l5.z * x22; x61 -= l5.w * x23; x61 -= l6.x * x24; x61 -= l6.y * x25; x61 -= l6.z * x26; x61 -= l6.w * x27; x61 -= l7.x * x28; x61 -= l7.y * x29; x61 -= l7.z * x30; x61 -= l7.w * x31; } __builtin_amdgcn_sched_barrier(0); { const v4f l8 = GDN_L4(61, 8); const v4f l9 = GDN_L4(61, 9); const v4f l10 = GDN_L4(61, 10); const v4f l11 = GDN_L4(61, 11); const v4f l12 = GDN_L4(61, 12); const v4f l13 = GDN_L4(61, 13); const v4f l14 = GDN_L4(61, 14); const v4f l15 = GDN_L4(61, 15); __builtin_amdgcn_sched_barrier(0); x61 -= l8.x * x32; x61 -= l8.y * x33; x61 -= l8.z * x34; x61 -= l8.w * x35; x61 -= l9.x * x36; x61 -= l9.y * x37; x61 -= l9.z * x38; x61 -= l9.w * x39; x61 -= l10.x * x40; x61 -= l10.y * x41; x61 -= l10.z * x42; x61 -= l10.w * x43; x61 -= l11.x * x44; x61 -= l11.y * x45; x61 -= l11.z * x46; x61 -= l11.w * x47; x61 -= l12.x * x48; x61 -= l12.y * x49; x61 -= l12.z * x50; x61 -= l12.w * x51; x61 -= l13.x * x52; x61 -= l13.y * x53; x61 -= l13.z * x54; x61 -= l13.w * x55; x61 -= l14.x * x56; x61 -= l14.y * x57; x61 -= l14.z * x58; x61 -= l14.w * x59; x61 -= l15.x * x60; } __builtin_amdgcn_sched_barrier(0);
        float x62 = GDN_RHS(62); { const v4f l0 = GDN_L4(62, 0); const v4f l1 = GDN_L4(62, 1); const v4f l2 = GDN_L4(62, 2); const v4f l3 = GDN_L4(62, 3); const v4f l4 = GDN_L4(62, 4); const v4f l5 = GDN_L4(62, 5); const v4f l6 = GDN_L4(62, 6); const v4f l7 = GDN_L4(62, 7); __builtin_amdgcn_sched_barrier(0); x62 -= l0.x * x0; x62 -= l0.y * x1; x62 -= l0.z * x2; x62 -= l0.w * x3; x62 -= l1.x * x4; x62 -= l1.y * x5; x62 -= l1.z * x6; x62 -= l1.w * x7; x62 -= l2.x * x8; x62 -= l2.y * x9; x62 -= l2.z * x10; x62 -= l2.w * x11; x62 -= l3.x * x12; x62 -= l3.y * x13; x62 -= l3.z * x14; x62 -= l3.w * x15; x62 -= l4.x * x16; x62 -= l4.y * x17; x62 -= l4.z * x18; x62 -= l4.w * x19; x62 -= l5.x * x20; x62 -= l5.y * x21; x62 -= l5.z * x22; x62 -= l5.w * x23; x62 -= l6.x * x24; x62 -= l6.y * x25; x62 -= l6.z * x26; x62 -= l6.w * x27; x62 -= l7.x * x28; x62 -= l7.y * x29; x62 -= l7.z * x30; x62 -= l7.w * x31; } __builtin_amdgcn_sched_barrier(0); { const v4f l8 = GDN_L4(62, 8); const v4f l9 = GDN_L4(62, 9); const v4f l10 = GDN_L4(62, 10); const v4f l11 = GDN_L4(62, 11); const v4f l12 = GDN_L4(62, 12); const v4f l13 = GDN_L4(62, 13); const v4f l14 = GDN_L4(62, 14); const v4f l15 = GDN_L4(62, 15); __builtin_amdgcn_sched_barrier(0); x62 -= l8.x * x32; x62 -= l8.y * x33; x62 -= l8.z * x34; x62 -= l8.w * x35; x62 -= l9.x * x36; x62 -= l9.y * x37; x62 -= l9.z * x38; x62 -= l9.w * x39; x62 -= l10.x * x40; x62 -= l10.y * x41; x62 -= l10.z * x42; x62 -= l10.w * x43; x62 -= l11.x * x44; x62 -= l11.y * x45; x62 -= l11.z * x46; x62 -= l11.w * x47; x62 -= l12.x * x48; x62 -= l12.y * x49; x62 -= l12.z * x50; x62 -= l12.w * x51; x62 -= l13.x * x52; x62 -= l13.y * x53; x62 -= l13.z * x54; x62 -= l13.w * x55; x62 -= l14.x * x56; x62 -= l14.y * x57; x62 -= l14.z * x58; x62 -= l14.w * x59; x62 -= l15.x * x60; x62 -= l15.y * x61; } __builtin_amdgcn_sched_barrier(0);
        float x63 = GDN_RHS(63); { const v4f l0 = GDN_L4(63, 0); const v4f l1 = GDN_L4(63, 1); const v4f l2 = GDN_L4(63, 2); const v4f l3 = GDN_L4(63, 3); const v4f l4 = GDN_L4(63, 4); const v4f l5 = GDN_L4(63, 5); const v4f l6 = GDN_L4(63, 6); const v4f l7 = GDN_L4(63, 7); __builtin_amdgcn_sched_barrier(0); x63 -= l0.x * x0; x63 -= l0.y * x1; x63 -= l0.z * x2; x63 -= l0.w * x3; x63 -= l1.x * x4; x63 -= l1.y * x5; x63 -= l1.z * x6; x63 -= l1.w * x7; x63 -= l2.x * x8; x63 -= l2.y * x9; x63 -= l2.z * x10; x63 -= l2.w * x11; x63 -= l3.x * x12; x63 -= l3.y * x13; x63 -= l3.z * x14; x63 -= l3.w * x15; x63 -= l4.x * x16; x63 -= l4.y * x17; x63 -= l4.z * x18; x63 -= l4.w * x19; x63 -= l5.x * x20; x63 -= l5.y * x21; x63 -= l5.z * x22; x63 -= l5.w * x23; x63 -= l6.x * x24; x63 -= l6.y * x25; x63 -= l6.z * x26; x63 -= l6.w * x27; x63 -= l7.x * x28; x63 -= l7.y * x29; x63 -= l7.z * x30; x63 -= l7.w * x31; } __builtin_amdgcn_sched_barrier(0); { const v4f l8 = GDN_L4(63, 8); const v4f l9 = GDN_L4(63, 9); const v4f l10 = GDN_L4(63, 10); const v4f l11 = GDN_L4(63, 11); const v4f l12 = GDN_L4(63, 12); const v4f l13 = GDN_L4(63, 13); const v4f l14 = GDN_L4(63, 14); const v4f l15 = GDN_L4(63, 15); __builtin_amdgcn_sched_barrier(0); x63 -= l8.x * x32; x63 -= l8.y * x33; x63 -= l8.z * x34; x63 -= l8.w * x35; x63 -= l9.x * x36; x63 -= l9.y * x37; x63 -= l9.z * x38; x63 -= l9.w * x39; x63 -= l10.x * x40; x63 -= l10.y * x41; x63 -= l10.z * x42; x63 -= l10.w * x43; x63 -= l11.x * x44; x63 -= l11.y * x45; x63 -= l11.z * x46; x63 -= l11.w * x47; x63 -= l12.x * x48; x63 -= l12.y * x49; x63 -= l12.z * x50; x63 -= l12.w * x51; x63 -= l13.x * x52; x63 -= l13.y * x53; x63 -= l13.z * x54; x63 -= l13.w * x55; x63 -= l14.x * x56; x63 -= l14.y * x57; x63 -= l14.z * x58; x63 -= l14.w * x59; x63 -= l15.x * x60; x63 -= l15.y * x61; x63 -= l15.z * x62; } __builtin_amdgcn_sched_barrier(0);
        if (c < 128) { GU[0 * 128 + c] = x0; GU[1 * 128 + c] = x1; GU[2 * 128 + c] = x2; GU[3 * 128 + c] = x3; GU[4 * 128 + c] = x4; GU[5 * 128 + c] = x5; GU[6 * 128 + c] = x6; GU[7 * 128 + c] = x7; GU[8 * 128 + c] = x8; GU[9 * 128 + c] = x9; GU[10 * 128 + c] = x10; GU[11 * 128 + c] = x11; GU[12 * 128 + c] = x12; GU[13 * 128 + c] = x13; GU[14 * 128 + c] = x14; GU[15 * 128 + c] = x15; GU[16 * 128 + c] = x16; GU[17 * 128 + c] = x17; GU[18 * 128 + c] = x18; GU[19 * 128 + c] = x19; GU[20 * 128 + c] = x20; GU[21 * 128 + c] = x21; GU[22 * 128 + c] = x22; GU[23 * 128 + c] = x23; GU[24 * 128 + c] = x24; GU[25 * 128 + c] = x25; GU[26 * 128 + c] = x26; GU[27 * 128 + c] = x27; GU[28 * 128 + c] = x28; GU[29 * 128 + c] = x29; GU[30 * 128 + c] = x30; GU[31 * 128 + c] = x31; GU[32 * 128 + c] = x32; GU[33 * 128 + c] = x33; GU[34 * 128 + c] = x34; GU[35 * 128 + c] = x35; GU[36 * 128 + c] = x36; GU[37 * 128 + c] = x37; GU[38 * 128 + c] = x38; GU[39 * 128 + c] = x39; GU[40 * 128 + c] = x40; GU[41 * 128 + c] = x41; GU[42 * 128 + c] = x42; GU[43 * 128 + c] = x43; GU[44 * 128 + c] = x44; GU[45 * 128 + c] = x45; GU[46 * 128 + c] = x46; GU[47 * 128 + c] = x47; GU[48 * 128 + c] = x48; GU[49 * 128 + c] = x49; GU[50 * 128 + c] = x50; GU[51 * 128 + c] = x51; GU[52 * 128 + c] = x52; GU[53 * 128 + c] = x53; GU[54 * 128 + c] = x54; GU[55 * 128 + c] = x55; GU[56 * 128 + c] = x56; GU[57 * 128 + c] = x57; GU[58 * 128 + c] = x58; GU[59 * 128 + c] = x59; GU[60 * 128 + c] = x60; GU[61 * 128 + c] = x61; GU[62 * 128 + c] = x62; GU[63 * 128 + c] = x63; }
        else { GNW[0 * 128 + (c - 128)] = (bf16)f2bf(-x0); GNW[1 * 128 + (c - 128)] = (bf16)f2bf(-x1); GNW[2 * 128 + (c - 128)] = (bf16)f2bf(-x2); GNW[3 * 128 + (c - 128)] = (bf16)f2bf(-x3); GNW[4 * 128 + (c - 128)] = (bf16)f2bf(-x4); GNW[5 * 128 + (c - 128)] = (bf16)f2bf(-x5); GNW[6 * 128 + (c - 128)] = (bf16)f2bf(-x6); GNW[7 * 128 + (c - 128)] = (bf16)f2bf(-x7); GNW[8 * 128 + (c - 128)] = (bf16)f2bf(-x8); GNW[9 * 128 + (c - 128)] = (bf16)f2bf(-x9); GNW[10 * 128 + (c - 128)] = (bf16)f2bf(-x10); GNW[11 * 128 + (c - 128)] = (bf16)f2bf(-x11); GNW[12 * 128 + (c - 128)] = (bf16)f2bf(-x12); GNW[13 * 128 + (c - 128)] = (bf16)f2bf(-x13); GNW[14 * 128 + (c - 128)] = (bf16)f2bf(-x14); GNW[15 * 128 + (c - 128)] = (bf16)f2bf(-x15); GNW[16 * 128 + (c - 128)] = (bf16)f2bf(-x16); GNW[17 * 128 + (c - 128)] = (bf16)f2bf(-x17); GNW[18 * 128 + (c - 128)] = (bf16)f2bf(-x18); GNW[19 * 128 + (c - 128)] = (bf16)f2bf(-x19); GNW[20 * 128 + (c - 128)] = (bf16)f2bf(-x20); GNW[21 * 128 + (c - 128)] = (bf16)f2bf(-x21); GNW[22 * 128 + (c - 128)] = (bf16)f2bf(-x22); GNW[23 * 128 + (c - 128)] = (bf16)f2bf(-x23); GNW[24 * 128 + (c - 128)] = (bf16)f2bf(-x24); GNW[25 * 128 + (c - 128)] = (bf16)f2bf(-x25); GNW[26 * 128 + (c - 128)] = (bf16)f2bf(-x26); GNW[27 * 128 + (c - 128)] = (bf16)f2bf(-x27); GNW[28 * 128 + (c - 128)] = (bf16)f2bf(-x28); GNW[29 * 128 + (c - 128)] = (bf16)f2bf(-x29); GNW[30 * 128 + (c - 128)] = (bf16)f2bf(-x30); GNW[31 * 128 + (c - 128)] = (bf16)f2bf(-x31); GNW[32 * 128 + (c - 128)] = (bf16)f2bf(-x32); GNW[33 * 128 + (c - 128)] = (bf16)f2bf(-x33); GNW[34 * 128 + (c - 128)] = (bf16)f2bf(-x34); GNW[35 * 128 + (c - 128)] = (bf16)f2bf(-x35); GNW[36 * 128 + (c - 128)] = (bf16)f2bf(-x36); GNW[37 * 128 + (c - 128)] = (bf16)f2bf(-x37); GNW[38 * 128 + (c - 128)] = (bf16)f2bf(-x38); GNW[39 * 128 + (c - 128)] = (bf16)f2bf(-x39); GNW[40 * 128 + (c - 128)] = (bf16)f2bf(-x40); GNW[41 * 128 + (c - 128)] = (bf16)f2bf(-x41); GNW[42 * 128 + (c - 128)] = (bf16)f2bf(-x42); GNW[43 * 128 + (c - 128)] = (bf16)f2bf(-x43); GNW[44 * 128 + (c - 128)] = (bf16)f2bf(-x44); GNW[45 * 128 + (c - 128)] = (bf16)f2bf(-x45); GNW[46 * 128 + (c - 128)] = (bf16)f2bf(-x46); GNW[47 * 128 + (c - 128)] = (bf16)f2bf(-x47); GNW[48 * 128 + (c - 128)] = (bf16)f2bf(-x48); GNW[49 * 128 + (c - 128)] = (bf16)f2bf(-x49); GNW[50 * 128 + (c - 128)] = (bf16)f2bf(-x50); GNW[51 * 128 + (c - 128)] = (bf16)f2bf(-x51); GNW[52 * 128 + (c - 128)] = (bf16)f2bf(-x52); GNW[53 * 128 + (c - 128)] = (bf16)f2bf(-x53); GNW[54 * 128 + (c - 128)] = (bf16)f2bf(-x54); GNW[55 * 128 + (c - 128)] = (bf16)f2bf(-x55); GNW[56 * 128 + (c - 128)] = (bf16)f2bf(-x56); GNW[57 * 128 + (c - 128)] = (bf16)f2bf(-x57); GNW[58 * 128 + (c - 128)] = (bf16)f2bf(-x58); GNW[59 * 128 + (c - 128)] = (bf16)f2bf(-x59); GNW[60 * 128 + (c - 128)] = (bf16)f2bf(-x60); GNW[61 * 128 + (c - 128)] = (bf16)f2bf(-x61); GNW[62 * 128 + (c - 128)] = (bf16)f2bf(-x62); GNW[63 * 128 + (c - 128)] = (bf16)f2bf(-x63); }
#undef GDN_RHS
#undef GDN_L4
    } else {
        const int t2 = tid - 256; const float gl = gcs[63];
        { const int i = t2 >> 2, d0 = (t2 & 3) * 32; const float e = __expf(gcs[i]);
#pragma unroll
          for (int x8 = 0; x8 < 4; ++x8) { const v4f a = *(const LAS v4f*)(qs + i * QP + d0 + 8 * x8), b = *(const LAS v4f*)(qs + i * QP + d0 + 8 * x8 + 4);
              v4u w; w.x = pk2(a.x * e, a.y * e); w.y = pk2(a.z * e, a.w * e); w.z = pk2(b.x * e, b.y * e); w.w = pk2(b.z * e, b.w * e); *(v4u*)(GQG + i * 128 + d0 + 8 * x8) = w; } }
        { const int d = t2 >> 1, j0 = (t2 & 1) * 32;
#pragma unroll
          for (int x8 = 0; x8 < 4; ++x8) { float o[8];
#pragma unroll
              for (int x = 0; x < 8; ++x) { const int j = j0 + 8 * x8 + x; o[x] = ks[j * QP + d] * __expf(gl - gcs[j]); }
              v4u w; w.x = pk2(o[0], o[1]); w.y = pk2(o[2], o[3]); w.z = pk2(o[4], o[5]); w.w = pk2(o[6], o[7]); *(v4u*)(GKT + d * 64 + j0 + 8 * x8) = w; } }
        if (t2 == 0) GDL[item] = __expf(gl);
    }
    __syncthreads();
}
struct GdnFrags { bf16x8_t nw[4], qg[4], at[2], kt[2][2]; float u[4]; float dl; };
__device__ __forceinline__ void gdn_load(GdnFrags& F, const Params& p, int item, int off128, int off64, int offk, int offu) {
    const bf16* GNW = (const bf16*)(p.ws + WS_GNW) + (size_t)item * 8192; const bf16* GQG = (const bf16*)(p.ws + WS_GQG) + (size_t)item * 8192;
    const bf16* GAT = (const bf16*)(p.ws + WS_GAT) + (size_t)item * 4096; const bf16* GKT = (const bf16*)(p.ws + WS_GKT) + (size_t)item * 8192; const float* GU = (const float*)(p.ws + WS_GU) + (size_t)item * 8192;
#pragma unroll
    for (int ks = 0; ks < 4; ++ks) { F.nw[ks] = *(const bf16x8_t*)(GNW + off128 + 32 * ks); F.qg[ks] = *(const bf16x8_t*)(GQG + off128 + 32 * ks); }
#pragma unroll
    for (int ks = 0; ks < 2; ++ks) { F.at[ks] = *(const bf16x8_t*)(GAT + off64 + 32 * ks); F.kt[0][ks] = *(const bf16x8_t*)(GKT + offk + 32 * ks); F.kt[1][ks] = *(const bf16x8_t*)(GKT + offk + 1024 + 32 * ks); }
#pragma unroll
    for (int r = 0; r < 4; ++r) F.u[r] = GU[offu + r * 128];
    F.dl = ((const float*)(p.ws + WS_GDL))[item];
}
constexpr int STP = 136, VNP = 72;
__device__ __forceinline__ void gdn_seq(const Params& p, LAS unsigned char* lds, int wgi, int wave, int lane) {
    const int u = wgi * 2 + (wave >> 2), wi = wave & 3, h = u >> 3, sl = u & 7, g = lane >> 4, c = lane & 15;
    LAS unsigned short* ST = (LAS unsigned short*)(lds + (wave >> 2) * 12288);
    LAS unsigned short* VNT = ST + 2 * 16 * STP;
    float* GO = (float*)(p.ws + WS_GO);
    const int off128 = (16 * wi + c) * 128 + 8 * g, off64 = (16 * wi + c) * 64 + 8 * g, offk = (32 * wi + c) * 64 + 8 * g, offu = (16 * wi + 4 * g) * 128 + 16 * sl + c;
#pragma unroll
    for (int mt = 0; mt < 2; ++mt) *(LAS v2u*)(ST + c * STP + 16 * (2 * wi + mt) + 4 * g) = (v2u){0u, 0u};
    pg8::f32x4 Sacc[2] = {{0.f, 0.f, 0.f, 0.f}, {0.f, 0.f, 0.f, 0.f}};
    __syncthreads();
    GdnFrags F0, F1;
    gdn_load(F0, p, h, off128, off64, offk, offu);
#define GDN_STEP(F, n_) do { const int cur = (n_) & 1; bf16x8_t sf[4]; \
        _Pragma("unroll") for (int ks = 0; ks < 4; ++ks) sf[ks] = *(const LAS bf16x8_t*)(ST + cur * 16 * STP + c * STP + 32 * ks + 8 * g); \
        pg8::f32x4 vn = {F.u[0], F.u[1], F.u[2], F.u[3]}; \
        _Pragma("unroll") for (int ks = 0; ks < 4; ++ks) vn = __builtin_amdgcn_mfma_f32_16x16x32_bf16(F.nw[ks], sf[ks], vn, 0, 0, 0); \
        { v2u w; w.x = pk2(vn[0], vn[1]); w.y = pk2(vn[2], vn[3]); *(LAS v2u*)(VNT + c * VNP + 16 * wi + 4 * g) = w; } \
        LDS_BAR(); \
        const bf16x8_t v0 = *(const LAS bf16x8_t*)(VNT + c * VNP + 8 * g), v1 = *(const LAS bf16x8_t*)(VNT + c * VNP + 32 + 8 * g); \
        pg8::f32x4 o = {0.f, 0.f, 0.f, 0.f}; \
        _Pragma("unroll") for (int ks = 0; ks < 4; ++ks) o = __builtin_amdgcn_mfma_f32_16x16x32_bf16(F.qg[ks], sf[ks], o, 0, 0, 0); \
        o = __builtin_amdgcn_mfma_f32_16x16x32_bf16(F.at[0], v0, o, 0, 0, 0); o = __builtin_amdgcn_mfma_f32_16x16x32_bf16(F.at[1], v1, o, 0, 0, 0); \
        { const size_t tb = (size_t)(n_) * 64 + 16 * wi + 4 * g; _Pragma("unroll") for (int r = 0; r < 4; ++r) GO[(tb + r) * BW + h * 128 + 16 * sl + c] = o[r]; } \
        _Pragma("unroll") for (int mt = 0; mt < 2; ++mt) { Sacc[mt] = Sacc[mt] * F.dl; \
            Sacc[mt] = __builtin_amdgcn_mfma_f32_16x16x32_bf16(F.kt[mt][0], v0, Sacc[mt], 0, 0, 0); Sacc[mt] = __builtin_amdgcn_mfma_f32_16x16x32_bf16(F.kt[mt][1], v1, Sacc[mt], 0, 0, 0); \
            v2u w; w.x = pk2(Sacc[mt][0], Sacc[mt][1]); w.y = pk2(Sacc[mt][2], Sacc[mt][3]); *(LAS v2u*)(ST + (cur ^ 1) * 16 * STP + c * STP + 16 * (2 * wi + mt) + 4 * g) = w; } \
        LDS_BAR(); } while (0)
    for (int n = 0; n < T / 64; n += 2) {
        gdn_load(F1, p, (n + 1) * 4 + h, off128, off64, offk, offu);
        GDN_STEP(F0, n);
        gdn_load(F0, p, ((n + 2 < T / 64) ? n + 2 : n) * 4 + h, off128, off64, offk, offu);
        GDN_STEP(F1, n + 1);
    }
#undef GDN_STEP
}

constexpr int SEQ_UOFF = 132096;
constexpr int GI_NW = 0, GI_QG = 8704, GI_AT = 17408, GI_KT = 22016, GI_SZ = 31232;
struct GdnStage { v4u r[7]; float u[4]; float dl; };
__device__ __forceinline__ void gdn_stage_load(GdnStage& Sg, const Params& p, int item, int tid, int offu) {
    const bf16* GNW = (const bf16*)(p.ws + WS_GNW) + (size_t)item * 8192; const bf16* GQG = (const bf16*)(p.ws + WS_GQG) + (size_t)item * 8192;
    const bf16* GAT = (const bf16*)(p.ws + WS_GAT) + (size_t)item * 4096; const bf16* GKT = (const bf16*)(p.ws + WS_GKT) + (size_t)item * 8192; const float* GU = (const float*)(p.ws + WS_GU) + (size_t)item * 8192;
    Sg.r[0] = *(const v4u*)(GNW + 8 * tid); Sg.r[1] = *(const v4u*)(GNW + 8 * (tid + 512)); Sg.r[2] = *(const v4u*)(GQG + 8 * tid); Sg.r[3] = *(const v4u*)(GQG + 8 * (tid + 512));
    Sg.r[4] = *(const v4u*)(GAT + 8 * tid); Sg.r[5] = *(const v4u*)(GKT + 8 * tid); Sg.r[6] = *(const v4u*)(GKT + 8 * (tid + 512));
#pragma unroll
    for (int r = 0; r < 4; ++r) Sg.u[r] = GU[offu + r * 128];
    Sg.dl = ((const float*)(p.ws + WS_GDL))[item];
}
__device__ __forceinline__ void gdn_stage_write(const GdnStage& Sg, LAS unsigned short* img, int tid) {
    { const int p0 = tid, p1 = tid + 512;
      *(LAS v4u*)(img + GI_NW + (p0 >> 4) * 136 + 8 * (p0 & 15)) = Sg.r[0]; *(LAS v4u*)(img + GI_NW + (p1 >> 4) * 136 + 8 * (p1 & 15)) = Sg.r[1];
      *(LAS v4u*)(img + GI_QG + (p0 >> 4) * 136 + 8 * (p0 & 15)) = Sg.r[2]; *(LAS v4u*)(img + GI_QG + (p1 >> 4) * 136 + 8 * (p1 & 15)) = Sg.r[3];
      *(LAS v4u*)(img + GI_AT + (p0 >> 3) * 72 + 8 * (p0 & 7)) = Sg.r[4];
      *(LAS v4u*)(img + GI_KT + (p0 >> 3) * 72 + 8 * (p0 & 7)) = Sg.r[5]; *(LAS v4u*)(img + GI_KT + (p1 >> 3) * 72 + 8 * (p1 & 7)) = Sg.r[6]; }
}
__device__ __forceinline__ void gdn_seq2(const Params& p, LAS unsigned char* lds, int wgi, int tid, int wave, int lane) {
    const int h = wgi >> 2, sl = 2 * (wgi & 3) + (wave >> 2), wi = wave & 3, g = lane >> 4, c = lane & 15;
    LAS unsigned short* IMG = (LAS unsigned short*)lds;
    LAS unsigned short* ST = (LAS unsigned short*)(lds + SEQ_UOFF + (wave >> 2) * 12288);
    LAS unsigned short* VNT = ST + 2 * 16 * STP;
    float* GO = (float*)(p.ws + WS_GO);
    const int offu = (16 * wi + 4 * g) * 128 + 16 * sl + c;
#pragma unroll
    for (int mt = 0; mt < 2; ++mt) *(LAS v2u*)(ST + c * STP + 16 * (2 * wi + mt) + 4 * g) = (v2u){0u, 0u};
    pg8::f32x4 Sacc[2] = {{0.f, 0.f, 0.f, 0.f}, {0.f, 0.f, 0.f, 0.f}};
    GdnStage A, B;
    gdn_stage_load(A, p, h, tid, offu); gdn_stage_write(A, IMG, tid);
    gdn_stage_load(B, p, 4 + h, tid, offu);
    LDS_BAR();
    constexpr int NCH = T / 64;
#define GDN_STEP2(X, Y, n_) do { const int cur = (n_) & 1; const LAS unsigned short* im = IMG + cur * GI_SZ; bf16x8_t sf[4]; \
        _Pragma("unroll") for (int ks = 0; ks < 4; ++ks) sf[ks] = *(const LAS bf16x8_t*)(ST + cur * 16 * STP + c * STP + 32 * ks + 8 * g); \
        pg8::f32x4 vn = {X.u[0], X.u[1], X.u[2], X.u[3]}; const float dl = X.dl; \
        _Pragma("unroll") for (int ks = 0; ks < 4; ++ks) vn = __builtin_amdgcn_mfma_f32_16x16x32_bf16(*(const LAS bf16x8_t*)(im + GI_NW + (16 * wi + c) * 136 + 32 * ks + 8 * g), sf[ks], vn, 0, 0, 0); \
        { v2u w; w.x = pk2(vn[0], vn[1]); w.y = pk2(vn[2], vn[3]); *(LAS v2u*)(VNT + c * VNP + 16 * wi + 4 * g) = w; } \
        pg8::f32x4 o = {0.f, 0.f, 0.f, 0.f}; \
        _Pragma("unroll") for (int ks = 0; ks < 4; ++ks) o = __builtin_amdgcn_mfma_f32_16x16x32_bf16(*(const LAS bf16x8_t*)(im + GI_QG + (16 * wi + c) * 136 + 32 * ks + 8 * g), sf[ks], o, 0, 0, 0); \
        LDS_BAR(); \
        gdn_stage_load(X, p, (((n_) + 2 < NCH) ? (n_) + 2 : (n_)) * 4 + h, tid, offu); \
        const bf16x8_t v0 = *(const LAS bf16x8_t*)(VNT + c * VNP + 8 * g), v1 = *(const LAS bf16x8_t*)(VNT + c * VNP + 32 + 8 * g); \
        o = __builtin_amdgcn_mfma_f32_16x16x32_bf16(*(const LAS bf16x8_t*)(im + GI_AT + (16 * wi + c) * 72 + 8 * g), v0, o, 0, 0, 0); \
        o = __builtin_amdgcn_mfma_f32_16x16x32_bf16(*(const LAS bf16x8_t*)(im + GI_AT + (16 * wi + c) * 72 + 32 + 8 * g), v1, o, 0, 0, 0); \
        { const size_t tb = (size_t)(n_) * 64 + 16 * wi + 4 * g; _Pragma("unroll") for (int r = 0; r < 4; ++r) GO[(tb + r) * BW + h * 128 + 16 * sl + c] = o[r]; } \
        _Pragma("unroll") for (int mt = 0; mt < 2; ++mt) { Sacc[mt] = Sacc[mt] * dl; \
            Sacc[mt] = __builtin_amdgcn_mfma_f32_16x16x32_bf16(*(const LAS bf16x8_t*)(im + GI_KT + (16 * (2 * wi + mt) + c) * 72 + 8 * g), v0, Sacc[mt], 0, 0, 0); \
            Sacc[mt] = __builtin_amdgcn_mfma_f32_16x16x32_bf16(*(const LAS bf16x8_t*)(im + GI_KT + (16 * (2 * wi + mt) + c) * 72 + 32 + 8 * g), v1, Sacc[mt], 0, 0, 0); \
            v2u w; w.x = pk2(Sacc[mt][0], Sacc[mt][1]); w.y = pk2(Sacc[mt][2], Sacc[mt][3]); *(LAS v2u*)(ST + (cur ^ 1) * 16 * STP + c * STP + 16 * (2 * wi + mt) + 4 * g) = w; } \
        gdn_stage_write(Y, IMG + (cur ^ 1) * GI_SZ, tid); \
        LDS_BAR(); } while (0)
    for (int n = 0; n < NCH; n += 2) { GDN_STEP2(A, B, n); GDN_STEP2(B, A, n + 1); }
#undef GDN_STEP2
}
constexpr int MI_Q = 0, MI_S = 4608, MI_K = 9216, MI_SZ = 13824;
struct MlStage { v4u r[3]; bf16x8_t vt[2]; float fl; };
__device__ __forceinline__ void ml_stage_load(MlStage& Sg, const Params& p, int item, int tid, int offV) {
    const bf16* MQ = (const bf16*)(p.ws + WS_MQ) + (size_t)item * 4096; const bf16* MS = (const bf16*)(p.ws + WS_MS) + (size_t)item * 4096; const bf16* MK = (const bf16*)(p.ws + WS_MK) + (size_t)item * 4096;
    const bf16* MV = (const bf16*)(p.ws + WS_MV) + (size_t)item * 9216;
    Sg.r[0] = *(const v4u*)(MQ + 8 * tid); Sg.r[1] = *(const v4u*)(MS + 8 * tid); Sg.r[2] = *(const v4u*)(MK + 8 * tid);
    Sg.vt[0] = *(const bf16x8_t*)(MV + offV); Sg.vt[1] = *(const bf16x8_t*)(MV + offV + 32);
    Sg.fl = ((const float*)(p.ws + WS_MFL))[item];
}
__device__ __forceinline__ void ml_stage_write(const MlStage& Sg, LAS unsigned short* img, int tid) {
    const int o = (tid >> 3) * 72 + 8 * (tid & 7);
    *(LAS v4u*)(img + MI_Q + o) = Sg.r[0]; *(LAS v4u*)(img + MI_S + o) = Sg.r[1]; *(LAS v4u*)(img + MI_K + o) = Sg.r[2];
}
__device__ __forceinline__ void ml_seq2(const Params& p, LAS unsigned char* lds, int wgi, int tid, int wave, int lane) {
    const int h = wgi / 5, sl0 = 2 * (wgi % 5) + (wave >> 2), wi = wave & 3, g = lane >> 4, c = lane & 15;
    const bool real = sl0 < 9; const int sl = real ? sl0 : 8;
    LAS unsigned short* IMG = (LAS unsigned short*)lds;
    LAS unsigned short* CT = (LAS unsigned short*)(lds + SEQ_UOFF + (wave >> 2) * 8192);
    float* HO = (float*)(p.ws + WS_HO); float* HDEN = (float*)(p.ws + WS_HDEN);
    const int offV = (16 * sl + c) * 64 + 8 * g;
    *(LAS v2u*)(CT + c * 72 + 16 * wi + 4 * g) = (v2u){0u, 0u};
    pg8::f32x4 Cacc = {0.f, 0.f, 0.f, 0.f};
    MlStage A, B;
    ml_stage_load(A, p, h, tid, offV); ml_stage_write(A, IMG, tid);
    ml_stage_load(B, p, 4 + h, tid, offV);
    LDS_BAR();
    constexpr int NCH = T / 64;
#define ML_STEP2(X, Y, n_) do { const int cur = (n_) & 1; const LAS unsigned short* im = IMG + cur * MI_SZ; const int ro = (16 * wi + c) * 72 + 8 * g; \
        const bf16x8_t c0 = *(const LAS bf16x8_t*)(CT + cur * 16 * 72 + c * 72 + 8 * g), c1 = *(const LAS bf16x8_t*)(CT + cur * 16 * 72 + c * 72 + 32 + 8 * g); \
        const bf16x8_t vt0 = X.vt[0], vt1 = X.vt[1]; const float fl = X.fl; \
        pg8::f32x4 num = {0.f, 0.f, 0.f, 0.f}; \
        num = __builtin_amdgcn_mfma_f32_16x16x32_bf16(*(const LAS bf16x8_t*)(im + MI_Q + ro), c0, num, 0, 0, 0); num = __builtin_amdgcn_mfma_f32_16x16x32_bf16(*(const LAS bf16x8_t*)(im + MI_Q + ro + 32), c1, num, 0, 0, 0); \
        num = __builtin_amdgcn_mfma_f32_16x16x32_bf16(*(const LAS bf16x8_t*)(im + MI_S + ro), vt0, num, 0, 0, 0); num = __builtin_amdgcn_mfma_f32_16x16x32_bf16(*(const LAS bf16x8_t*)(im + MI_S + ro + 32), vt1, num, 0, 0, 0); \
        Cacc = Cacc * fl; \
        Cacc = __builtin_amdgcn_mfma_f32_16x16x32_bf16(*(const LAS bf16x8_t*)(im + MI_K + ro), vt0, Cacc, 0, 0, 0); Cacc = __builtin_amdgcn_mfma_f32_16x16x32_bf16(*(const LAS bf16x8_t*)(im + MI_K + ro + 32), vt1, Cacc, 0, 0, 0); \
        ml_stage_load(X, p, (((n_) + 2 < NCH) ? (n_) + 2 : (n_)) * 4 + h, tid, offV); \
        { v2u w; w.x = pk2(Cacc[0], Cacc[1]); w.y = pk2(Cacc[2], Cacc[3]); *(LAS v2u*)(CT + (cur ^ 1) * 16 * 72 + c * 72 + 16 * wi + 4 * g) = w; } \
        { const size_t tb = (size_t)(n_) * 64 + 16 * wi + 4 * g; \
          if (sl < 8) { _Pragma("unroll") for (int r = 0; r < 4; ++r) HO[(tb + r) * BW + h * 128 + 16 * sl + c] = num[r]; } \
          else if (c == 0 && real) { _Pragma("unroll") for (int r = 0; r < 4; ++r) HDEN[(tb + r) * 4 + h] = num[r]; } } \
        ml_stage_write(Y, IMG + (cur ^ 1) * MI_SZ, tid); \
        LDS_BAR(); } while (0)
    for (int n = 0; n < NCH; n += 2) { ML_STEP2(A, B, n); ML_STEP2(B, A, n + 1); }
#undef ML_STEP2
}

__device__ __forceinline__ void mixer_gmlp_item(const Params& p, int l, LAS unsigned char* lds, int item, int tid, int wave, int lane) {
    const int chunk = item >> 2, g = item & 3; const size_t tok0 = (size_t)chunk * 128;
    const bf16* Z = (const bf16*)(p.ws + WS_Z); bf16* BR1 = (bf16*)(p.ws + WS_BR) + 1 * BW;
    const float* ng = p.in[I_GMNG] + l * BW; const float* nb = p.in[I_GMNB] + l * BW;
    const float* wsp = p.in[I_GMWS] + ((size_t)(l * 4 + g) * 128) * 128; const float* bsp = p.in[I_GMBS] + (l * 4 + g) * 128;
    LAS float* vn = (LAS float*)lds;
    for (int r = 0; r < 16; ++r) { const int tk = wave * 16 + r;
        const v4u raw = *(const v4u*)(Z + (tok0 + tk) * ZC + ZC_GMV + 8 * lane); float x[8]; unpack8(raw, x); float s = 0.f;
#pragma unroll
        for (int i = 0; i < 8; ++i) { x[i] = gelu_tanh(x[i]); s += x[i]; }
        const float mean = wave_sum(s) * (1.f / 512.f); float ss = 0.f;
#pragma unroll
        for (int i = 0; i < 8; ++i) { x[i] -= mean; ss += x[i] * x[i]; }
        const float rstd = rsqrtf(wave_sum(ss) * (1.f / 512.f) + LN_EPS);
        if ((lane >> 4) == g) { const int cl = 8 * (lane & 15);
#pragma unroll
            for (int i = 0; i < 8; ++i) vn[tk * 128 + cl + i] = x[i] * rstd * ng[8 * lane + i] + nb[8 * lane + i]; }
    }
    __syncthreads();
    const int t = tid >> 2, cq = tid & 3; float acc[32];
#pragma unroll
    for (int i = 0; i < 32; ++i) acc[i] = 0.f;
    const float* wrow = wsp + (size_t)t * 128;
    for (int s = 0; s <= t; ++s) { const float w = wrow[s]; const LAS float* row = vn + s * 128 + cq * 32;
#pragma unroll
        for (int i4 = 0; i4 < 8; ++i4) { const v4f a = *(const LAS v4f*)(row + 4 * i4); acc[4 * i4] += w * a.x; acc[4 * i4 + 1] += w * a.y; acc[4 * i4 + 2] += w * a.z; acc[4 * i4 + 3] += w * a.w; } }
    const float bias = bsp[t];
#pragma unroll
    for (int i8 = 0; i8 < 4; ++i8) { const v4u raw = *(const v4u*)(Z + (tok0 + t) * ZC + ZC_GMU + g * 128 + cq * 32 + 8 * i8); float u[8]; unpack8(raw, u); float o[8];
#pragma unroll
        for (int i = 0; i < 8; ++i) o[i] = gelu_tanh(u[i]) * (acc[8 * i8 + i] + bias);
#if MERGE_FP8
        *(v2u*)((unsigned char*)(p.ws + WS_BR) + (tok0 + t) * BRW + 1 * BW + g * 128 + cq * 32 + 8 * i8) = (v2u){pk4_f8(o[0], o[1], o[2], o[3], BRSC), pk4_f8(o[4], o[5], o[6], o[7], BRSC)}; }
#else
        v4u w; w.x = pk2(o[0], o[1]); w.y = pk2(o[2], o[3]); w.z = pk2(o[4], o[5]); w.w = pk2(o[6], o[7]);
        *(v4u*)(BR1 + (tok0 + t) * BRW + g * 128 + cq * 32 + 8 * i8) = w; }
#endif
    __syncthreads();
}

__device__ __forceinline__ void vt_item(const Params& p, LAS unsigned char* lds, int item, int tid) {
    const int h = item & 3, n = item >> 2; const size_t t0 = (size_t)n * 64;
    const bf16* Z = (const bf16*)(p.ws + WS_Z); bf16* VT = (bf16*)(p.ws + WS_VT);
    LAS unsigned short* vs = (LAS unsigned short*)lds;
#pragma unroll
    for (int r = 0; r < 2; ++r) { const int idx = tid + 512 * r, tk = idx >> 4, c8 = idx & 15;
        *(LAS v4u*)(vs + tk * 136 + 8 * c8) = *(const v4u*)(Z + (t0 + tk) * ZC + ZC_SBV + h * 128 + 8 * c8); }
    __syncthreads();
    { const int d = tid >> 2, jq = tid & 3; unsigned w[8];
#pragma unroll
      for (int x = 0; x < 8; ++x) w[x] = (unsigned)vs[(16 * jq + 2 * x) * 136 + d] | ((unsigned)vs[(16 * jq + 2 * x + 1) * 136 + d] << 16);
      bf16* dst = VT + ((size_t)h * 128 + d) * T + t0 + 16 * jq;
      *(v4u*)dst = (v4u){w[0], w[1], w[2], w[3]}; *(v4u*)(dst + 8) = (v4u){w[4], w[5], w[6], w[7]}; }
    __syncthreads();
}
constexpr int KTP = 136, VTP = 72;
__device__ __forceinline__ void sb_unit(const Params& p, LAS unsigned char* lds, int unit, int tid, int wave, int lane) {
    const int h = unit >> 6, q0 = (unit & 63) * 128, g = lane >> 4, c = lane & 15; const int qrow = q0 + 16 * wave + c;
    const bf16* Z = (const bf16*)(p.ws + WS_Z); const bf16* VT = (const bf16*)(p.ws + WS_VT) + (size_t)h * 128 * T; bf16* BR0 = (bf16*)(p.ws + WS_BR);
    LAS unsigned short* Kt = (LAS unsigned short*)lds;
    LAS unsigned short* Vt = Kt + 2 * 64 * KTP;
    LAS int* flags = (LAS int*)(Vt + 2 * 128 * VTP);
    bf16x8_t qf[4];
#pragma unroll
    for (int ks = 0; ks < 4; ++ks) qf[ks] = *(const bf16x8_t*)(Z + (size_t)qrow * ZC + ZC_SBQ + h * 128 + 32 * ks + 8 * g);
    pg8::f32x4 acc[8];
#pragma unroll
    for (int dt = 0; dt < 8; ++dt) acc[dt] = (pg8::f32x4){0.f, 0.f, 0.f, 0.f};
    float racc = 0.f;
    v4u kr[2], vr[2];
    const int jt = (q0 >> 6) + 1;
#define SB_GLOAD(j_) do { _Pragma("unroll") for (int r = 0; r < 2; ++r) { const int idx = tid + 512 * r; \
        kr[r] = *(const v4u*)(Z + (size_t)(64 * (j_) + (idx >> 4)) * ZC + ZC_SBK + h * 128 + 8 * (idx & 15)); \
        vr[r] = *(const v4u*)(VT + (size_t)(idx >> 3) * T + 64 * (j_) + 8 * (idx & 7)); } } while (0)
#define SB_LWRITE(b_) do { _Pragma("unroll") for (int r = 0; r < 2; ++r) { const int idx = tid + 512 * r; \
        *(LAS v4u*)(Kt + (b_) * 64 * KTP + (idx >> 4) * KTP + 8 * (idx & 15)) = kr[r]; *(LAS v4u*)(Vt + (b_) * 128 * VTP + (idx >> 3) * VTP + 8 * (idx & 7)) = vr[r]; } } while (0)
    LDS_BAR();
    SB_GLOAD(jt); SB_LWRITE(0);
    LDS_BAR();
    for (int j = jt, it = 0; j >= 0; --j, ++it) {
        const int cur = it & 1;
        SB_GLOAD(j > 0 ? j - 1 : 0);
        const bool wdone = __all(racc > 104.f);
        if (64 * j < q0 + 16 * wave + 15 && !wdone) {
            const LAS unsigned short* Kc = Kt + cur * 64 * KTP; const LAS unsigned short* Vc = Vt + cur * 128 * VTP;
            pg8::f32x4 z[4];
#pragma unroll
            for (int s = 0; s < 4; ++s) { z[s] = (pg8::f32x4){0.f, 0.f, 0.f, 0.f};
#pragma unroll
                for (int ks = 0; ks < 4; ++ks) z[s] = __builtin_amdgcn_mfma_f32_16x16x32_bf16(*(const LAS bf16x8_t*)(Kc + (16 * s + c) * KTP + 32 * ks + 8 * g), qf[ks], z[s], 0, 0, 0); }
            float sp[4][4], t[4], xs[4]; bool mk[4][4];
#pragma unroll
            for (int s = 0; s < 4; ++s) { t[s] = 0.f;
#pragma unroll
                for (int r = 0; r < 4; ++r) { const int key = 64 * j + 16 * s + 4 * g + r; mk[s][r] = key < qrow; const float zz = z[s][r] * 0.08838834764831845f; z[s][r] = zz;
                    sp[s][r] = mk[s][r] ? softplusf_(zz) : 0.f; t[s] += sp[s][r]; } }
            float grand = 0.f, higher[4];
#pragma unroll
            for (int s = 3; s >= 0; --s) { float x = t[s]; float y = __shfl(x, lane + 16); x += (g < 3) ? y : 0.f; y = __shfl(x, lane + 32); x += (g < 2) ? y : 0.f;
                xs[s] = x - t[s];
                const float tot = __shfl(x, c); higher[s] = grand; grand += tot; }
            bf16x8_t pf[2];
#pragma unroll
            for (int s = 0; s < 4; ++s) { float a[4]; float e = 0.f;
#pragma unroll
                for (int r = 3; r >= 0; --r) { const float la = z[s][r] - sp[s][r] - (racc + higher[s] + xs[s] + e); a[r] = mk[s][r] ? __expf(la) : 0.f; e += sp[s][r]; }
                const unsigned w0 = pk2(a[0], a[1]), w1 = pk2(a[2], a[3]);
                if ((s & 1) == 0) { pf[s >> 1][0] = (short)(w0 & 0xffff); pf[s >> 1][1] = (short)(w0 >> 16); pf[s >> 1][2] = (short)(w1 & 0xffff); pf[s >> 1][3] = (short)(w1 >> 16); }
                else              { pf[s >> 1][4] = (short)(w0 & 0xffff); pf[s >> 1][5] = (short)(w0 >> 16); pf[s >> 1][6] = (short)(w1 & 0xffff); pf[s >> 1][7] = (short)(w1 >> 16); } }
            racc += grand;
#pragma unroll
            for (int dt = 0; dt < 8; ++dt)
#pragma unroll
                for (int k2 = 0; k2 < 2; ++k2) { const v2u lo = *(const LAS v2u*)(Vc + (16 * dt + c) * VTP + 32 * k2 + 4 * g), hi = *(const LAS v2u*)(Vc + (16 * dt + c) * VTP + 32 * k2 + 16 + 4 * g);
                    const v4u vv = (v4u){lo.x, lo.y, hi.x, hi.y};
                    acc[dt] = __builtin_amdgcn_mfma_f32_16x16x32_bf16(__builtin_bit_cast(bf16x8_t, vv), pf[k2], acc[dt], 0, 0, 0); }
        }
        const bool wd2 = __all(racc > 104.f);
        if (lane == 0) flags[cur * 8 + wave] = wd2 ? 1 : 0;
        SB_LWRITE(cur ^ 1);
        LDS_BAR();
        int alld = 1;
#pragma unroll
        for (int w = 0; w < 8; ++w) alld &= flags[cur * 8 + w];
        if (alld) break;
    }
#undef SB_GLOAD
#undef SB_LWRITE
#pragma unroll
#if MERGE_FP8
    for (int dt = 0; dt < 8; ++dt) *(unsigned*)((unsigned char*)BR0 + (size_t)qrow * BRW + h * 128 + 16 * dt + 4 * g) = pk4_f8(acc[dt][0], acc[dt][1], acc[dt][2], acc[dt][3], BRSC);
#else
    for (int dt = 0; dt < 8; ++dt) { v2u w; w.x = pk2(acc[dt][0], acc[dt][1]); w.y = pk2(acc[dt][2], acc[dt][3]); *(v2u*)(BR0 + (size_t)qrow * BRW + h * 128 + 16 * dt + 4 * g) = w; }
#endif
}

__device__ __forceinline__ void phase_mixers(const Params& p, int l, LAS unsigned char* lds, int wg, int G, int tid, int wave, int lane, const XcdBarrier& bar) {
#if defined(PROBE_SPLIT)
    if (wg < 16) gdn_seq2(p, lds, wg, tid, wave, lane); else if (wg < 36) ml_seq2(p, lds, wg - 16, tid, wave, lane);
    xcd_barrier(bar);
    const int w2 = wg, G2 = G;
#else
    if (wg < 16) { gdn_seq2(p, lds, wg, tid, wave, lane); return; }
    if (wg < 36) { ml_seq2(p, lds, wg - 16, tid, wave, lane); return; }
    const int w2 = wg - 36, G2 = G - 36;
#endif
    for (int it = w2; it < 256; it += G2) mixer_gmlp_item(p, l, lds, it, tid, wave, lane);
    for (int it = w2; it < 256; it += G2) sb_unit(p, lds, it, tid, wave, lane);
#if !defined(PROBE_CONV0)
    __syncthreads();
    {
        constexpr int NIT1 = (NEX * 2 * (D / 64) * (ED / 32)) + (NEX * (ED / 64) * (D / 32));
        const int nheavy = (G2 < 256 && 2 * G2 >= 256) ? 256 - G2 : 0, per_wave = NIT1 / (G2 * 8);
        const int NA = (nheavy > 0 && per_wave > 2 * CONV_SKIP) ? (per_wave - CONV_SKIP) * (G2 * 8) : NIT1;
        phase_convert<1>(p, l, lds, w2 * 8 + wave, G2 * 8, wave, lane, false, 0, NA);
        if (NA < NIT1 && w2 >= nheavy) phase_convert<1>(p, l, lds, (w2 - nheavy) * 8 + wave, (G2 - nheavy) * 8, wave, lane, false, NA, NIT1); }
#endif
}

__device__ __forceinline__ void phase_post(const Params& p, int l, int gw, int NGW, int lane) {
    const bf16* Z = (const bf16*)(p.ws + WS_Z); const float* GO = (const float*)(p.ws + WS_GO); const float* HO = (const float*)(p.ws + WS_HO); const float* HDEN = (const float*)(p.ws + WS_HDEN);
    bf16* BR2 = (bf16*)(p.ws + WS_BR) + 2 * BW; bf16* BR3 = (bf16*)(p.ws + WS_BR) + 3 * BW;
    const float* gng = p.in[I_GDNNG] + l * 128; const float* mng = p.in[I_MLNG] + l * BW;
    for (int t = gw; t < T; t += NGW) {
        {   const v4f a0 = *(const v4f*)(GO + (size_t)t * BW + 8 * lane), a1 = *(const v4f*)(GO + (size_t)t * BW + 8 * lane + 4); float o[8] = {a0.x, a0.y, a0.z, a0.w, a1.x, a1.y, a1.z, a1.w}; float ss = 0.f;
#pragma unroll
            for (int i = 0; i < 8; ++i) ss += o[i] * o[i];
            const float r = rsqrtf(sum16(ss) * (1.f / 128.f) + LN_EPS);
            const v4u graw = *(const v4u*)(Z + (size_t)t * ZC + ZC_GDNG + 8 * lane); float gt[8]; unpack8(graw, gt);
#pragma unroll
            for (int i = 0; i < 8; ++i) o[i] = o[i] * r * gng[(8 * lane + i) & 127] * siluf_(gt[i]);
#if MERGE_FP8
            *(v2u*)((unsigned char*)(p.ws + WS_BR) + (size_t)t * BRW + 2 * BW + 8 * lane) = (v2u){pk4_f8(o[0], o[1], o[2], o[3], BRSC), pk4_f8(o[4], o[5], o[6], o[7], BRSC)}; }
#else
            v4u w; w.x = pk2(o[0], o[1]); w.y = pk2(o[2], o[3]); w.z = pk2(o[4], o[5]); w.w = pk2(o[6], o[7]); *(v4u*)(BR2 + (size_t)t * BRW + 8 * lane) = w; }
#endif
        {   const v4f a0 = *(const v4f*)(HO + (size_t)t * BW + 8 * lane), a1 = *(const v4f*)(HO + (size_t)t * BW + 8 * lane + 4); float o[8] = {a0.x, a0.y, a0.z, a0.w, a1.x, a1.y, a1.z, a1.w}; float ss = 0.f;
            const float dn = __builtin_amdgcn_rcpf(fmaxf(fabsf(HDEN[(size_t)t * 4 + (lane >> 4)]), 1.f));
#pragma unroll
            for (int i = 0; i < 8; ++i) { o[i] *= dn; ss += o[i] * o[i]; }
            const float r = rsqrtf(sum16(ss) * (1.f / 128.f) + LN_EPS);
            const v4u graw = *(const v4u*)(Z + (size_t)t * ZC + ZC_MLO + 8 * lane); float gt[8]; unpack8(graw, gt);
#pragma unroll
            for (int i = 0; i < 8; ++i) o[i] = o[i] * r * mng[8 * lane + i] * sigmoidf_(gt[i]);
#if MERGE_FP8
            *(v2u*)((unsigned char*)(p.ws + WS_BR) + (size_t)t * BRW + 3 * BW + 8 * lane) = (v2u){pk4_f8(o[0], o[1], o[2], o[3], BRSC), pk4_f8(o[4], o[5], o[6], o[7], BRSC)}; }
#else
            v4u w; w.x = pk2(o[0], o[1]); w.y = pk2(o[2], o[3]); w.z = pk2(o[4], o[5]); w.w = pk2(o[6], o[7]); *(v4u*)(BR3 + (size_t)t * BRW + 8 * lane) = w; }
#endif
    }
}

__device__ __forceinline__ void ln_row(const float* yrow, const float* g, const float* b, int lane, v4f (&v)[8]) {
    const v4f* yr = (const v4f*)yrow + lane; float s = 0.f;
#pragma unroll
    for (int j = 0; j < 8; ++j) { v[j] = yr[64 * j]; s += (v[j].x + v[j].y) + (v[j].z + v[j].w); }
    const float mean = wave_sum(s) * (1.f / D); float s2 = 0.f;
#pragma unroll
    for (int j = 0; j < 8; ++j) { v[j] = v[j] - mean; s2 += (v[j].x * v[j].x + v[j].y * v[j].y) + (v[j].z * v[j].z + v[j].w * v[j].w); }
    const float rstd = rsqrtf(wave_sum(s2) * (1.f / D) + LN_EPS);
#pragma unroll
    for (int j = 0; j < 8; ++j) { const v4f gg = ((const v4f*)g)[lane + 64 * j], bb = ((const v4f*)b)[lane + 64 * j]; v[j] = v[j] * rstd * gg + bb; }
}
constexpr int RT_XP = 2052;
constexpr int RT_TAB = 131072 + 1024;
__device__ __forceinline__ void phase_ln1_router(const Params& p, int l, LAS unsigned char* lds, int wg, int G, int wave, int lane, int cnt_shift = 0) {
    const bf16* Y = (const bf16*)(p.ws + WS_Y); bf16* X1 = (bf16*)(p.ws + WS_X1); bf16* X1B = (bf16*)(p.ws + WS_X1B); int* LIST = (int*)(p.ws + WS_LIST); float* WL = (float*)(p.ws + WS_WL); unsigned* SLOT = (unsigned*)(p.ws + WS_SLOT);
    unsigned* cnt = (unsigned*)(p.ws + WS_CTL) + CW_CNT + l * 4096 + cnt_shift;
    const float* g1 = p.in[I_LN1G] + (size_t)l * D; const float* b1 = p.in[I_LN1B] + (size_t)l * D;
    const float* wr = p.in[I_WR] + (size_t)l * D * NE; const float rbias = p.in[I_RB][l * NE + lane];
    LAS float* xt = (LAS float*)lds;
    LAS float* part = (LAS float*)lds;
    LAS unsigned char* selm = lds + RT_TAB; LAS unsigned char* rkm = selm + 4096; LAS float* wtm = (LAS float*)(rkm + 4096); LAS unsigned* basem = (LAS unsigned*)(wtm + 4096);
    const int n_l = lane & 15, kq = lane >> 4;
    int gi = 0;
    for (int tg = wg; tg < T / 16; tg += G, ++gi) {
        {   v4f va[8], vb[8]; const size_t m0 = (size_t)tg * 16 + 2 * wave;
#pragma unroll
            for (int j = 0; j < 8; ++j) { va[j] = ld4(Y, m0 * D + 4 * lane + 256 * j, true); vb[j] = ld4(Y, (m0 + 1) * D + 4 * lane + 256 * j, true); }
            float sa = 0.f, sb = 0.f;
#pragma unroll
            for (int j = 0; j < 8; ++j) { sa += (va[j].x + va[j].y) + (va[j].z + va[j].w); sb += (vb[j].x + vb[j].y) + (vb[j].z + vb[j].w); }
            const float ma = wave_sum(sa) * (1.f / D), mb = wave_sum(sb) * (1.f / D); float qa = 0.f, qb = 0.f;
#pragma unroll
            for (int j = 0; j < 8; ++j) { va[j] = va[j] - ma; vb[j] = vb[j] - mb; qa += (va[j].x * va[j].x + va[j].y * va[j].y) + (va[j].z * va[j].z + va[j].w * va[j].w); qb += (vb[j].x * vb[j].x + vb[j].y * vb[j].y) + (vb[j].z * vb[j].z + vb[j].w * vb[j].w); }
            const float ra = rsqrtf(wave_sum(qa) * (1.f / D) + LN_EPS), rb = rsqrtf(wave_sum(qb) * (1.f / D) + LN_EPS);
#pragma unroll
            for (int j = 0; j < 8; ++j) { const v4f gg = ((const v4f*)g1)[lane + 64 * j], bb = ((const v4f*)b1)[lane + 64 * j]; va[j] = va[j] * ra * gg + bb; vb[j] = vb[j] * rb * gg + bb; }
#pragma unroll
            for (int rr = 0; rr < 2; ++rr) { const size_t m = m0 + rr; v2u* xo = (v2u*)(X1 + m * D) + lane;
#pragma unroll
                for (int j = 0; j < 8; ++j) { const v4f v = rr ? vb[j] : va[j]; xo[64 * j] = (v2u){pk2(v.x, v.y), pk2(v.z, v.w)};
#if MOE_UP_FP8
                    { unsigned w = 0; w = __builtin_amdgcn_cvt_pk_fp8_f32(v.x, v.y, w, false); w = __builtin_amdgcn_cvt_pk_fp8_f32(v.z, v.w, w, true); ((unsigned*)((unsigned char*)X1B + m * D))[lane + 64 * j] = w; }
#else
                    { v2u o; o.x = pk2(v.x, v.y); o.y = pk2(v.z, v.w); ((v2u*)(X1B + m * D))[lane + 64 * j] = o; }
#endif
                    *(LAS v4f*)(xt + (2 * wave + rr) * RT_XP + 4 * lane + 256 * j) = v; } } }
        __syncthreads();
        {   pg8::f32x4 acc[4];
#pragma unroll
            for (int i = 0; i < 4; ++i) acc[i] = (pg8::f32x4){0.f, 0.f, 0.f, 0.f};
            const float* wb = wr + (size_t)(256 * wave + 4 * kq) * NE + 4 * n_l;
            const LAS float* xa = xt + n_l * RT_XP + 256 * wave + 4 * kq;
            v4f bwa[16], bwb[16];
#define RT_LOADW(dst, sb_) do { _Pragma("unroll") for (int q = 0; q < 16; ++q) dst[q] = *(const v4f*)(wb + (size_t)(16 * (4 * (sb_) + (q >> 2)) + (q & 3)) * NE); } while (0)
#define RT_MMA(src, sb_) do { _Pragma("unroll") for (int sg = 0; sg < 4; ++sg) { const v4f a4 = *(const LAS v4f*)(xa + 16 * (4 * (sb_) + sg)); \
                _Pragma("unroll") for (int c = 0; c < 4; ++c) { const v4f b4 = src[sg * 4 + c]; const float a = c == 0 ? a4.x : c == 1 ? a4.y : c == 2 ? a4.z : a4.w; \
                    acc[0] = __builtin_amdgcn_mfma_f32_16x16x4f32(a, b4.x, acc[0], 0, 0, 0); acc[1] = __builtin_amdgcn_mfma_f32_16x16x4f32(a, b4.y, acc[1], 0, 0, 0); \
                    acc[2] = __builtin_amdgcn_mfma_f32_16x16x4f32(a, b4.z, acc[2], 0, 0, 0); acc[3] = __builtin_amdgcn_mfma_f32_16x16x4f32(a, b4.w, acc[3], 0, 0, 0); } } } while (0)
            RT_LOADW(bwa, 0);
#pragma unroll 1
            for (int h = 0; h < 2; ++h) {
                RT_LOADW(bwb, 1); RT_MMA(bwa, 0);
                if (h == 0) RT_LOADW(bwa, 2);
                RT_MMA(bwb, 1);
                wb += (size_t)128 * NE; xa += 128; asm volatile("" : "+v"(wb));
            }
#undef RT_LOADW
#undef RT_MMA
            __syncthreads();
#pragma unroll
            for (int j = 0; j < 4; ++j) *(LAS v4f*)(part + (wave * 16 + 4 * kq + j) * 64 + 4 * n_l) = (v4f){acc[0][j], acc[1][j], acc[2][j], acc[3][j]}; }
        __syncthreads();
#pragma unroll 1
        for (int rr = 0; rr < 2; ++rr) { const int lr = wave + 8 * rr; float logit = 0.f;
#pragma unroll
            for (int w = 0; w < 8; ++w) logit += part[(w * 16 + lr) * 64 + lane];
            const float s = sigmoid_div(logit), biased = s + rbias;
            const float m1 = max8(biased); const float li = (float)(lane & 7);
            const float first = min8(biased == m1 ? li : 8.f);
            const float m2 = max8(li == first ? -INFINITY : biased);
            const float gs = m1 + m2; const int myg = lane >> 3; int grank = 0;
#pragma unroll
            for (int g2 = 0; g2 < 8; ++g2) { const float o = __builtin_bit_cast(float, __builtin_amdgcn_readlane(__builtin_bit_cast(int, gs), g2 * 8)); grank += (o > gs || (o == gs && g2 < myg)) ? 1 : 0; }
            const float masked = grank < 4 ? biased : -INFINITY; int rank = 0;
#pragma unroll
            for (int e2 = 0; e2 < 64; ++e2) { const float o = __builtin_bit_cast(float, __builtin_amdgcn_readlane(__builtin_bit_cast(int, masked), e2)); rank += (o > masked || (o == masked && e2 < lane)) ? 1 : 0; }
            const float wsel = rank < 6 ? s : 0.f; const float tot = wave_sum(wsel);
            const int ri = gi * 16 + lr;
            selm[ri * 64 + lane] = (rank < 6) ? 1 : 0; rkm[ri * 64 + lane] = (unsigned char)rank; wtm[ri * 64 + lane] = wsel / tot * 2.5f; }
        __syncthreads();
    }
    const int nrows = gi * 16;
    if (wave == 0) { unsigned n = 0;
        for (int r = 0; r < nrows; ++r) n += selm[r * 64 + lane];
        unsigned base = 0; if (n && !(PROBE_NOATOM && cnt_shift)) base = __hip_atomic_fetch_add(cnt + 64 * lane, n, __ATOMIC_RELAXED, __HIP_MEMORY_SCOPE_AGENT);
        basem[lane] = base; }
    __syncthreads();
    for (int ri = wave; ri < nrows; ri += 8) { unsigned pos = basem[lane];
        for (int r = 0; r < ri; ++r) pos += selm[r * 64 + lane];
        if (selm[ri * 64 + lane]) { const size_t m = (size_t)(wg + (ri >> 4) * G) * 16 + (ri & 15); const int rk = rkm[ri * 64 + lane];
            LIST[lane * T + pos] = (int)m; WL[lane * T + pos] = wtm[ri * 64 + lane]; SLOT[m * 8 + rk] = ((unsigned)lane << 16) | pos; } }
    __syncthreads();
}
__device__ __forceinline__ void phase_combine_ln2(const Params& p, int l, void* dst, bool dbf, int gw, int NGW, int lane) {
    const bf16* X1 = (const bf16*)(p.ws + WS_X1); const bf16* YE = (const bf16*)(p.ws + WS_YEXP); const unsigned* SLOT = (const unsigned*)(p.ws + WS_SLOT);
    const unsigned* cnt = (const unsigned*)(p.ws + WS_CTL) + CW_CNT + l * 4096;
    const float* g2 = p.in[I_LN2G] + (size_t)l * D; const float* b2 = p.in[I_LN2B] + (size_t)l * D;
    const int tiles = ((int)cnt[64 * lane] + 255) >> 8; const float incl = wave_scan_incl((float)tiles);
    const int toff = (int)incl - tiles;
    const int tsh = __builtin_amdgcn_readlane((int)incl, 63);
    for (int m = gw; m < T; m += NGW) {
        v4f v[8];
#pragma unroll
        for (int j = 0; j < 8; ++j) v[j] = ld4(X1, (size_t)m * D + 4 * lane + 256 * j, true) * ALPHA;
#pragma unroll
        for (int k = 0; k < 7; ++k) { size_t row;
            if (k == 0) row = (size_t)tsh * 256 + m;
            else { const unsigned s = __builtin_amdgcn_readfirstlane(SLOT[(size_t)m * 8 + (k - 1)]); const int e = (int)(s >> 16); row = (size_t)__builtin_amdgcn_readlane(toff, e) * 256 + (s & 0xffffu); }
            const v2u* yr = (const v2u*)(YE + row * D) + lane;
#pragma unroll
            for (int j = 0; j < 8; ++j) { const v2u y = yr[64 * j]; v[j].x += bflo(y.x); v[j].y += bfhi(y.x); v[j].z += bflo(y.y); v[j].w += bfhi(y.y); } }
        float s = 0.f;
#pragma unroll
        for (int j = 0; j < 8; ++j) s += (v[j].x + v[j].y) + (v[j].z + v[j].w);
        const float mean = wave_sum(s) * (1.f / D); float s2 = 0.f;
#pragma unroll
        for (int j = 0; j < 8; ++j) { v[j] = v[j] - mean; s2 += (v[j].x * v[j].x + v[j].y * v[j].y) + (v[j].z * v[j].z + v[j].w * v[j].w); }
        const float rstd = rsqrtf(wave_sum(s2) * (1.f / D) + LN_EPS);
#pragma unroll
        for (int j = 0; j < 8; ++j) { const v4f gg = ((const v4f*)g2)[lane + 64 * j], bb = ((const v4f*)b2)[lane + 64 * j]; const v4f o = v[j] * rstd * gg + bb;
            if (dbf) ((v2u*)((bf16*)dst + (size_t)m * D))[lane + 64 * j] = (v2u){pk2(o.x, o.y), pk2(o.z, o.w)};
            else ((v4f*)((float*)dst + (size_t)m * D))[lane + 64 * j] = o; }
    }
}

constexpr int NPH = 11;
template <class S> struct DupOrder {
    S s; int n;
    __device__ __forceinline__ bool next(int i, Unit& u) const { return s.next(i >= n ? i - n : i, u); }
    __device__ __forceinline__ int row_token(int i, int r) const { return s.row_token(i >= n ? i - n : i, r); }
    __device__ __forceinline__ void a_ready(const Unit& u) const { s.a_ready(u); }
    __device__ __forceinline__ void done(const Unit& u) const { s.done(u); }
};
template <class S> __device__ __forceinline__ int count_units(const S& s) { Unit u; int n = 0; while (n < 64 && s.next(n, u)) ++n; return n; }
#define ORDER_T(k, T) typename std::conditional<PROBE_DUP == (k), DupOrder<T>, T>::type
template <class S> __device__ __forceinline__ DupOrder<S> make_order(const S& s, std::true_type) { DupOrder<S> d{s, count_units(s)}; d.n = count_units(s); return d; }
template <class S> __device__ __forceinline__ S make_order(const S& s, std::false_type) { return s; }
#define MAKE_ORDER(k, s) make_order(s, std::integral_constant<bool, PROBE_DUP == (k)>())
template <int l>
__device__ __forceinline__ void run_layer(const Params& p, LAS unsigned char* lds, const XcdBarrier& bar, int tid, int lane, int wave, int G, int wg, int gw, int NGW) {
    unsigned char* ws = p.ws;
    {
        const void* xin = (l == 0) ? (const void*)p.in[I_X] : (const void*)(ws + WS_XCUR);
        void* xout = (l == NL - 1) ? (void*)p.out : (void*)(ws + WS_XCUR);
#ifndef PROBE_DUP
#define PROBE_DUP (-1)
#endif
#define IS_GEMM_PH(k) ((k) == 1 || (k) == 5 || (k) == 6 || (k) == 8 || (k) == 9)
#define REP(k) _Pragma("nounroll") for (int _r = 0; _r < ((PROBE_DUP == (k) && !IS_GEMM_PH(k)) ? 2 + (p.ph_lo >> 20) : 1); ++_r)
#ifndef PH_MASK
#define PH_MASK 0x7ff
#endif
#define RUN(k) (((PH_MASK >> (k)) & 1) && p.ph_lo <= l * NPH + (k) && l * NPH + (k) < p.ph_hi)
#define SEAM(k) do { if (l * NPH + (k) + 1 < p.ph_hi) xcd_barrier(bar); } while (0)
        if (RUN(0)) { REP(0) { phase_convert<0>(p, l, lds, gw, NGW, wave, lane);
#if defined(PROBE_CONV0)
            phase_convert<1>(p, l, lds, gw, NGW, wave, lane);
#endif
 phase_xprep(p, l, xin, l > 0, lds, gw, NGW, tid, lane); } SEAM(0); }
        if (RUN(1)) { REP(1) { pg8::Gemm g{(const bf16*)(ws + WS_XB), (const bf16*)(ws + WS_WIN), T, ZC, D / 2, D / 2, D / 2}; pg8::StaticOrder S; S.init(T, ZC, G, wg);
            pg8::EpiBf16<0> E{(bf16*)(ws + WS_Z), ZC, nullptr, 0, 0, 1.f / 64.f};
            auto S2 = MAKE_ORDER(1, S); pg8::gemm_phase<pg8::EpiBf16<0>, ORDER_T(1, pg8::StaticOrder), true, true, true>(lds, g, S2, E); } SEAM(1); }
        if (RUN(2)) { REP(2) { for (int it = wg; it < 1536; it += G) { if (it < 512) gdn_pre_item(p, l, lds, it, tid, wave, lane); else if (it < 1024) ml_pre_item(p, l, lds, it - 512, tid, wave, lane); else vt_item(p, lds, it - 1024, tid); } } SEAM(2); }
        if (RUN(3)) { REP(3) { phase_mixers(p, l, lds, wg, G, tid, wave, lane, bar); } SEAM(3); }
        if (RUN(4)) { REP(4) { phase_post(p, l, gw, NGW, lane); } SEAM(4); }
        if (RUN(5)) { REP(5) { constexpr int KM = MERGE_FP8 ? BRW / 2 : BRW; pg8::Gemm g{(const bf16*)(ws + WS_BR), (const bf16*)(ws + WS_WBR), T, D, KM, KM, KM}; pg8::StaticOrder S; S.init(T, D, G, wg);
            EpiMergeH E{(const bf16*)(ws + WS_Z), (bf16*)(ws + WS_MSUM)};
            auto S2 = MAKE_ORDER(5, S); pg8::gemm_phase<EpiMergeH, ORDER_T(5, pg8::StaticOrder), true, true, MERGE_FP8 != 0>(lds, g, S2, E); } SEAM(5); }
        if (RUN(6)) { REP(6) { pg8::Gemm g{(const bf16*)(ws + WS_MSUM), (const bf16*)(ws + WS_WOUT), T, D, D / 2, D / 2, D / 2}; pg8::StaticOrder S; S.init(T, D, G, wg);
            EpiResid E{xin, (bf16*)(ws + WS_Y), 1.f / 64.f, l > 0};
            auto S2 = MAKE_ORDER(6, S); pg8::gemm_phase<EpiResid, ORDER_T(6, pg8::StaticOrder), true, true, true>(lds, g, S2, E); } SEAM(6); }
        if (RUN(7)) { REP(7) { phase_ln1_router(p, l, lds, wg, G, wave, lane, (PROBE_DUP == 7 && _r == 0) ? 16384 : 0); } SEAM(7); }
        if (RUN(8)) { REP(8) { const unsigned* cnt = (const unsigned*)(ws + WS_CTL) + CW_CNT + l * 4096; MoeTab M(lds); moe_tables(M, cnt, tid, lane, wave);
            UpOrder S{M, 0}; S.n = up_order_build(M, (const int*)(ws + WS_LIST), (const float*)(ws + WS_WL), wg, G, tid);
            constexpr int KU = MOE_UP_FP8 ? D / 2 : D;
            pg8::Gemm g{(const bf16*)(ws + WS_X1B), (const bf16*)(ws + WS_WUP), T, NEX * 1024, KU, KU, KU};
            EpiGluSparse E{(LAS const float*)M.wt, (bf16*)(ws + WS_HB)};
            auto S2 = MAKE_ORDER(8, S); pg8::gemm_phase_gather<EpiGluSparse, ORDER_T(8, UpOrder), MOE_UP_FP8 != 0>(lds, g, S2, E); } SEAM(8); }
        if (RUN(9)) { REP(9) { const unsigned* cnt = (const unsigned*)(ws + WS_CTL) + CW_CNT + l * 4096; MoeTab M(lds); moe_tables(M, cnt, tid, lane, wave);
            DownOrder S{M, G, wg, 8 * M.t[65]};
            constexpr int KD = MOE_DN_FP8 ? ED / 2 : ED;
            pg8::Gemm g{(const bf16*)(ws + WS_HB), (const bf16*)(ws + WS_WDN), HROWS, NEX * D, KD, KD, KD};
            EpiYexp E{(bf16*)(ws + WS_YEXP)};
            auto S2 = MAKE_ORDER(9, S); pg8::gemm_phase<EpiYexp, ORDER_T(9, DownOrder), true, true, MOE_DN_FP8 != 0>(lds, g, S2, E); } SEAM(9); }
        if (RUN(10)) { REP(10) { phase_combine_ln2(p, l, xout, l != NL - 1, gw, NGW, lane); } SEAM(10); }
#undef RUN
#undef SEAM
    }
}
__global__ void __launch_bounds__(512, 2) fwd_kernel(Params p) {
    extern __shared__ __attribute__((aligned(16))) unsigned char lds_raw[];
    LAS unsigned char* lds = (LAS unsigned char*)lds_raw;
    const int tid = threadIdx.x, lane = tid & 63, wave = __builtin_amdgcn_readfirstlane(tid >> 6);
    const int G = gridDim.x, wg = blockIdx.x, gw = wg * 8 + wave, NGW = G * 8;
    volatile LAS unsigned* MISC = (volatile LAS unsigned*)(lds + MISC_OFF);
    if (tid < 32) MISC[tid] = 0u;
    __syncthreads();
    unsigned* ctl = (unsigned*)(p.ws + WS_CTL);
    const bool multi = (p.ph_hi - p.ph_lo) > 1;
    XcdBarrier bar; bar.bar = ctl + CW_BAR; bar.x = 0; bar.st = nullptr;
    if (multi) bar = xcd_barrier_post(ctl + CW_BAR, MISC + 8);
    run_layer<0>(p, lds, bar, tid, lane, wave, G, wg, gw, NGW);
    run_layer<1>(p, lds, bar, tid, lane, wave, G, wg, gw, NGW);
}

#ifndef MK_MULTI_LAUNCH
#define MK_MULTI_LAUNCH 0
#endif
extern "C" void kernel_launch(void* const* d_in, const int* in_sizes, int n_in, void* d_out, int out_size, void* d_ws, size_t ws_size, hipStream_t stream) {
    static int grid = 0;
    if (grid == 0) {
        if (n_in != 27 || out_size != T * D || ws_size < WS_END) { fprintf(stderr, "kernel_launch: unexpected shapes (n_in %d out %d ws %zu need %zu)\n", n_in, out_size, ws_size, (size_t)WS_END); grid = -1; return; }
        int dev = 0, cus = 0, per_cu = 0;
        if (hipGetDevice(&dev) != hipSuccess || hipDeviceGetAttribute(&cus, hipDeviceAttributeMultiprocessorCount, dev) != hipSuccess) { grid = -1; return; }
        if (hipFuncSetAttribute((const void*)fwd_kernel, hipFuncAttributeMaxDynamicSharedMemorySize, LDS_BYTES) != hipSuccess) { fprintf(stderr, "kernel_launch: hipFuncSetAttribute failed\n"); grid = -1; return; }
        if (hipOccupancyMaxActiveBlocksPerMultiprocessor(&per_cu, (const void*)fwd_kernel, 512, LDS_BYTES) != hipSuccess || per_cu < 1) { fprintf(stderr, "kernel_launch: occupancy query says %d\n", per_cu); }
        (void)hipGetLastError();
        grid = cus;
    }
    if (grid < 0) return;
    (void)hipMemsetAsync((char*)d_ws + WS_CTL, 0, CTL_ZERO_BYTES, stream);
    Params p{};
    for (int i = 0; i < 27; ++i) p.in[i] = (const float*)d_in[i];
    p.out = (float*)d_out; p.ws = (unsigned char*)d_ws;
#if MK_MULTI_LAUNCH
    for (int ph = 0; ph < NL * NPH; ++ph) { p.ph_lo = ph; p.ph_hi = ph + 1; hipLaunchKernelGGL(fwd_kernel, dim3(grid), dim3(512), LDS_BYTES, stream, p); }
#else
    p.ph_lo = 0; p.ph_hi = NL * NPH; hipLaunchKernelGGL(fwd_kernel, dim3(grid), dim3(512), LDS_BYTES, stream, p);
#endif
}
```

```cpp
#include <hip/hip_runtime.h>
#include <cstdio>
#include <cstdint>
#include <type_traits>
namespace pg8 {
#define PG8_LAS __attribute__((address_space(3)))
typedef unsigned short bf16_t;
typedef short bf16x8 __attribute__((ext_vector_type(8)));
typedef float f32x4 __attribute__((ext_vector_type(4)));
typedef unsigned u32x4 __attribute__((ext_vector_type(4)));
constexpr int BM = 256, BK = 64, HALF = 128, HTB = HALF * BK * 2  , STAGE_BYTES = 8 * HTB, NXCD = 8, WGM = 8;

__host__ __device__ __forceinline__ int lds_byte(int r, int c) { const int st = (r >> 4) * 2 + (c >> 5), rr = r & 15, cc = c & 31, ob = rr * 64 + cc * 2; return st * 1024 + (ob ^ (((ob >> 9) & 1) << 5)); }
__host__ __device__ __forceinline__ void stage_rc(int b, int& R, int& C) { const int st = b / 1024, sb = b % 1024, swz = sb ^ (((sb >> 9) & 1) << 5); R = (st >> 1) * 16 + swz / 64; C = (st & 1) * 32 + (swz % 64) / 2; }
__host__ __device__ __forceinline__ int perm32(int rho) { const int n = rho >> 4, i = rho & 15; return 8 * (i >> 2) + 4 * n + (i & 3); }

struct Unit { int pm, pn, aux; };
struct Gemm { const bf16_t* A; const bf16_t* Bt; int M, N, K, lda, ldb; };

struct StaticOrder {
    int nM, nN, nwg, G, c;
    __host__ __device__ void init(int M, int N, int G_, int c_) { nM = M / BM; nN = N / BM; nwg = nM * nN; G = G_; c = c_; }
    __host__ __device__ bool next(int i, Unit& u) const {
        const long L = (long)i * G + c; if (L >= nwg) return false;
        int wgid = (int)L; { const int q = nwg / NXCD, r = nwg % NXCD, xcd = wgid % NXCD, off = wgid / NXCD; wgid = (xcd < r ? xcd * (q + 1) : r * (q + 1) + (xcd - r) * q) + off; }
        const int nig = WGM * nN, gid = wgid / nig, fm = gid * WGM, gsz = (nM - fm) < WGM ? (nM - fm) : WGM;
        u.pm = fm + ((wgid % nig) % gsz); u.pn = (wgid % nig) / gsz; return true;
    }
    __device__ __forceinline__ void a_ready(const Unit&) const {}
    __device__ __forceinline__ void done(const Unit&) const {}
};

__device__ __forceinline__ unsigned cvt_pk_bf16(float lo, float hi) { unsigned r; asm volatile("v_cvt_pk_bf16_f32 %0, %1, %2" : "=v"(r) : "v"(lo), "v"(hi)); return r; }
typedef float f32x2 __attribute__((ext_vector_type(2)));
__device__ __forceinline__ f32x2 gelu_pk(f32x2 v) {
    const f32x2 av = __builtin_elementwise_abs(v), d = av * 0.2316418882f + 1.0f;
    f32x2 t; t.x = __builtin_amdgcn_rcpf(d.x); t.y = __builtin_amdgcn_rcpf(d.y);
    f32x2 q = t * 0.5307027145f + (-0.7265760135f); q = q * t + 0.7107068705f; q = q * t + (-0.142248368f); q = q * t + 0.127414796f; q = q * t;
    const f32x2 s = (v * v) * (-0.72134752044f);
    f32x2 e; e.x = __builtin_amdgcn_exp2f(s.x); e.y = __builtin_amdgcn_exp2f(s.y);
    const f32x2 m = v * (q * e), r = v - m;
    f32x2 o; o.x = v.x < 0.f ? m.x : r.x; o.y = v.y < 0.f ? m.y : r.y; return o;
}

template <int ACT  > struct EpiBf16 {
    static constexpr bool PERM = true, AFTER_DRAIN = false; static constexpr int MID = 0; static_assert(ACT == 0 || ACT == 1, "EpiBf16: ACT is 0 (none) or 1 (gelu_pk)");
    bf16_t* O; int ldc; const float* bias; int split_cols; size_t split_stride; float scale0;
    __device__ __forceinline__ void operator()(const f32x4 (&acc)[2][2][4][2], const Unit& u, int wr, int wc, int fr, int fq) const {
        const int row0 = u.pm * BM + wr * 64 + fr; int colt = u.pn * BM; bf16_t* base = O;
        float sc = scale0; if (split_cols) { const int t = colt / split_cols; base += (size_t)t * split_stride; colt -= t * split_cols; if (t != 0) sc = 1.f; }
        const int col0 = colt + wc * 32 + 8 * fq, bcol0 = u.pn * BM + wc * 32 + 8 * fq;
        f32x4 bv[2][2];
#pragma unroll
        for (int bj = 0; bj < 2; ++bj)
#pragma unroll
            for (int n = 0; n < 2; ++n) bv[bj][n] = bias ? *(const f32x4*)(bias + bcol0 + bj * HALF + 4 * n) : (f32x4){0.f, 0.f, 0.f, 0.f};
#pragma unroll
        for (int ai = 0; ai < 2; ++ai)
#pragma unroll
            for (int m = 0; m < 4; ++m) { bf16_t* rowp = base + (size_t)(row0 + ai * HALF + m * 16) * ldc + col0;
#pragma unroll
                for (int bj = 0; bj < 2; ++bj) { f32x4 v0 = acc[ai][bj][m][0] + bv[bj][0], v1 = acc[ai][bj][m][1] + bv[bj][1];
                    if (ACT == 1) { f32x2 a = gelu_pk((f32x2){v0[0], v0[1]}), b = gelu_pk((f32x2){v0[2], v0[3]}), c = gelu_pk((f32x2){v1[0], v1[1]}), d = gelu_pk((f32x2){v1[2], v1[3]});
                        v0 = (f32x4){a.x, a.y, b.x, b.y}; v1 = (f32x4){c.x, c.y, d.x, d.y}; }
                    v0 = v0 * sc; v1 = v1 * sc; u32x4 w; w.x = cvt_pk_bf16(v0[0], v0[1]); w.y = cvt_pk_bf16(v0[2], v0[3]); w.z = cvt_pk_bf16(v1[0], v1[1]); w.w = cvt_pk_bf16(v1[2], v1[3]);
                    *(u32x4*)(rowp + bj * HALF) = w; } }
    }
};

typedef int i32x8 __attribute__((ext_vector_type(8)));
__device__ __forceinline__ i32x8 cat8(const bf16x8 a, const bf16x8 b) { typedef int i32x4 __attribute__((ext_vector_type(4))); const i32x4 x = __builtin_bit_cast(i32x4, a), y = __builtin_bit_cast(i32x4, b); return (i32x8){x[0], x[1], x[2], x[3], y[0], y[1], y[2], y[3]}; }
__device__ __forceinline__ bf16x8 lo8(const i32x8 v) { typedef int i32x4 __attribute__((ext_vector_type(4))); return __builtin_bit_cast(bf16x8, __builtin_shufflevector(v, v, 0, 1, 2, 3)); }
__device__ __forceinline__ bf16x8 hi8(const i32x8 v) { typedef int i32x4 __attribute__((ext_vector_type(4))); return __builtin_bit_cast(bf16x8, __builtin_shufflevector(v, v, 4, 5, 6, 7)); }
template <class Epi, class Sched, bool ALIGN_EPI = false, bool SP2 = false, bool FP8 = false>
__device__ __forceinline__ void gemm_phase(PG8_LAS unsigned char* lds, const Gemm g, const Sched& S, const Epi& E) {
    const int tid = threadIdx.x, wid = __builtin_amdgcn_readfirstlane(tid >> 6), lane = tid & 63, wr = wid >> 2, wc = wid & 3, fr = lane & 15, fq = lane >> 4;
    const int K = g.K, nt = K / BK;
    unsigned voffA[2], voffB[2];
#pragma unroll
    for (int i = 0; i < 2; ++i) { int R, C; stage_rc(tid * 16 + i * 8192, R, C); const int Rb = Epi::PERM ? ((R & ~31) + perm32(R & 31)) : R;
        voffA[i] = (unsigned)(R * g.lda + C) * 2u; voffB[i] = (unsigned)(Rb * g.ldb + C) * 2u; }
    const size_t kstep = (size_t)(BK * 2);
    const size_t hstepA = (size_t)HALF * g.lda * 2, hstepB = (size_t)HALF * g.ldb * 2;
    const size_t tstepA = 2 * hstepA, tstepB = 2 * hstepB;
    const unsigned ldsw = (unsigned)wid * 1024u;
    const int aoff = lds_byte(wr * 64 + fr, fq * 8), boff = lds_byte(wc * 32 + fr, fq * 8);
#define PG8_SA(b, h) (((b) * 2 + (h)) * HTB)
#define PG8_SB(b, h) ((4 + (b) * 2 + (h)) * HTB)
#define PG8_STAGE(bufoff, gbase, voff) do { _Pragma("unroll") for (int _i = 0; _i < 2; ++_i) \
        __builtin_amdgcn_global_load_lds((const unsigned*)((const char*)(gbase) + (voff)[_i]), (PG8_LAS unsigned*)(lds + (bufoff) + ldsw + _i * 8192), 16, 0, 0); } while (0)
#define PG8_LDA(dst, b, h) do { _Pragma("unroll") for (int m = 0; m < 4; ++m) { if constexpr (FP8) dst##8[m] = cat8(*(const PG8_LAS bf16x8*)(lds + PG8_SA(b, h) + aoff + m * 2048), *(const PG8_LAS bf16x8*)(lds + PG8_SA(b, h) + aoff + m * 2048 + 1024)); \
        else { _Pragma("unroll") for (int k = 0; k < 2; ++k) dst[m][k] = *(const PG8_LAS bf16x8*)(lds + PG8_SA(b, h) + aoff + m * 2048 + k * 1024); } } } while (0)
#define PG8_LDB(dst, b, h) do { _Pragma("unroll") for (int n = 0; n < 2; ++n) { if constexpr (FP8) dst##8[n] = cat8(*(const PG8_LAS bf16x8*)(lds + PG8_SB(b, h) + boff + n * 2048), *(const PG8_LAS bf16x8*)(lds + PG8_SB(b, h) + boff + n * 2048 + 1024)); \
        else { _Pragma("unroll") for (int k = 0; k < 2; ++k) dst[n][k] = *(const PG8_LAS bf16x8*)(lds + PG8_SB(b, h) + boff + n * 2048 + k * 1024); } } } while (0)
#define PG8_MMA(ai, bj, At, Bt) do { __builtin_amdgcn_s_setprio(1); _Pragma("unroll") for (int m = 0; m < 4; ++m) _Pragma("unroll") for (int n = 0; n < 2; ++n) { \
        if constexpr (FP8) asm volatile("v_mfma_scale_f32_16x16x128_f8f6f4 %0, %1, %2, %0, %3, %3 op_sel_hi:[0,0,0]" : "+v"(acc[ai][bj][m][n]) : "v"(Bt##8[n]), "v"(At##8[m]), "v"(fp8_unit_scale)); \
        else { _Pragma("unroll") for (int k = 0; k < 2; ++k) acc[ai][bj][m][n] = __builtin_amdgcn_mfma_f32_16x16x32_bf16(Bt[n][k], At[m][k], acc[ai][bj][m][n], 0, 0, 0); } } __builtin_amdgcn_s_setprio(0); } while (0)
#define PG8_WAIT_V(n) asm volatile("s_waitcnt vmcnt(" #n ")" ::: "memory")
#define PG8_WAIT_L(n) asm volatile("s_waitcnt lgkmcnt(" #n ")" ::: "memory")
#define PG8_BAR __builtin_amdgcn_s_barrier()
#define PG8_SCHED __builtin_amdgcn_sched_barrier(0)
    Unit cur, nxt; int ui = 0;
    if (!S.next(0, cur)) return;
    f32x4 acc[2][2][4][2];
#pragma unroll
    for (int a = 0; a < 2; ++a)
#pragma unroll
        for (int b = 0; b < 2; ++b)
#pragma unroll
            for (int m = 0; m < 4; ++m)
#pragma unroll
                for (int n = 0; n < 2; ++n) acc[a][b][m][n] = (f32x4){0.f, 0.f, 0.f, 0.f};
    int fp8_unit_scale = 0x7F7F7F7F; asm volatile("" : "+v"(fp8_unit_scale));
    bf16x8 At[4][2], B0[2][2], B1[2][2];
    i32x8 At8[4], B08[2], B18[2];
    const char* cA = (const char*)g.A + (size_t)cur.pm * tstepA; const char* cB = (const char*)g.Bt + (size_t)cur.pn * tstepB;
    S.a_ready(cur);
    if constexpr (SP2) {
        PG8_STAGE(PG8_SB(0, 0), cB, voffB); PG8_STAGE(PG8_SB(0, 1), cB + hstepB, voffB); PG8_STAGE(PG8_SA(0, 0), cA, voffA); PG8_STAGE(PG8_SA(0, 1), cA + hstepA, voffA);
        if (wr == 1) PG8_BAR;
        PG8_WAIT_V(2); PG8_BAR;
        PG8_STAGE(PG8_SB(1, 0), cB + kstep, voffB); PG8_STAGE(PG8_SA(1, 0), cA + kstep, voffA); PG8_STAGE(PG8_SB(1, 1), cB + hstepB + kstep, voffB);
        PG8_WAIT_V(6); PG8_BAR;
    } else {
        PG8_STAGE(PG8_SB(0, 0), cB, voffB); PG8_STAGE(PG8_SA(0, 0), cA, voffA); PG8_STAGE(PG8_SB(0, 1), cB + hstepB, voffB); PG8_STAGE(PG8_SA(0, 1), cA + hstepA, voffA);
        if (wr == 1) PG8_BAR;
        PG8_WAIT_V(4); PG8_BAR;
        PG8_STAGE(PG8_SB(1, 0), cB + kstep, voffB); PG8_STAGE(PG8_SA(1, 0), cA + kstep, voffA); PG8_STAGE(PG8_SB(1, 1), cB + hstepB + kstep, voffB);
        PG8_WAIT_V(6); PG8_BAR;
    }
    for (;;) {
        const bool has_next = S.next(ui + 1, nxt);
        const char* nA = has_next ? (const char*)g.A + (size_t)nxt.pm * tstepA : cA; const char* nB = has_next ? (const char*)g.Bt + (size_t)nxt.pn * tstepB : cB;
        for (int t = 0; t < nt; t += 2) {
            const bool last = (t == nt - 2);
            const char* a1 = cA + (size_t)(t + 1) * kstep;
            const char* a2 = last ? nA : cA + (size_t)(t + 2) * kstep; const char* b2 = last ? nB : cB + (size_t)(t + 2) * kstep;
            const char* a3 = a2 + kstep; const char* b3 = b2 + kstep;
            if (last && has_next) S.a_ready(nxt);
            if constexpr (SP2) {
            if constexpr (Epi::MID > 0) { if (t != 0 && (t % Epi::MID) == 0) { PG8_SCHED; if constexpr (FP8) asm volatile("s_nop 7\n\ts_nop 7" ::: "memory"); E.mid(acc, cur, t / Epi::MID, wr, wc, fr, fq); if constexpr (FP8) asm volatile("s_nop 7" ::: "memory"); PG8_SCHED; } }
            PG8_LDB(B0, 0, 0); PG8_LDB(B1, 0, 1); PG8_SCHED; PG8_LDA(At, 0, 0); PG8_STAGE(PG8_SA(1, 1), a1 + hstepA, voffA);
            PG8_WAIT_V(8); PG8_WAIT_L(0); PG8_BAR; PG8_MMA(0, 0, At, B0); PG8_MMA(0, 1, At, B1); PG8_BAR; PG8_SCHED;
            PG8_LDA(At, 0, 1); PG8_STAGE(PG8_SB(0, 0), b2, voffB); PG8_STAGE(PG8_SB(0, 1), b2 + hstepB, voffB); PG8_STAGE(PG8_SA(0, 0), a2, voffA);
            PG8_WAIT_V(8); PG8_WAIT_L(0); PG8_BAR; PG8_MMA(1, 0, At, B0); PG8_MMA(1, 1, At, B1); PG8_BAR; PG8_SCHED;
            PG8_LDB(B0, 1, 0); PG8_LDB(B1, 1, 1); PG8_SCHED; PG8_LDA(At, 1, 0); PG8_STAGE(PG8_SA(0, 1), a2 + hstepA, voffA);
            PG8_WAIT_V(8); PG8_WAIT_L(0); PG8_BAR; PG8_MMA(0, 0, At, B0); PG8_MMA(0, 1, At, B1); PG8_BAR; PG8_SCHED;
            PG8_LDA(At, 1, 1); PG8_STAGE(PG8_SB(1, 0), b3, voffB); PG8_STAGE(PG8_SB(1, 1), b3 + hstepB, voffB); PG8_STAGE(PG8_SA(1, 0), a3, voffA);
            PG8_WAIT_V(8); PG8_WAIT_L(0); PG8_BAR; PG8_MMA(1, 0, At, B0); PG8_MMA(1, 1, At, B1); PG8_BAR; PG8_SCHED;
            } else {
            PG8_LDB(B0, 0, 0); PG8_SCHED; PG8_LDA(At, 0, 0); PG8_STAGE(PG8_SA(1, 1), a1 + hstepA, voffA);
            PG8_WAIT_L(8); PG8_BAR; PG8_WAIT_L(0); PG8_MMA(0, 0, At, B0); PG8_BAR; PG8_SCHED;
            PG8_LDB(B1, 0, 1); PG8_STAGE(PG8_SB(0, 0), b2, voffB);
            PG8_BAR; PG8_WAIT_L(0); PG8_MMA(0, 1, At, B1); PG8_BAR;
            PG8_LDA(At, 0, 1); PG8_STAGE(PG8_SA(0, 0), a2, voffA);
            PG8_BAR; PG8_WAIT_L(0); PG8_MMA(1, 0, At, B0); PG8_BAR; PG8_SCHED;
            PG8_STAGE(PG8_SB(0, 1), b2 + hstepB, voffB);
            PG8_WAIT_V(6); PG8_BAR; PG8_MMA(1, 1, At, B1); PG8_BAR;
            PG8_LDB(B0, 1, 0); PG8_SCHED; PG8_LDA(At, 1, 0); PG8_STAGE(PG8_SA(0, 1), a2 + hstepA, voffA);
            PG8_WAIT_L(8); PG8_BAR; PG8_WAIT_L(0); PG8_MMA(0, 0, At, B0); PG8_BAR; PG8_SCHED;
            PG8_LDB(B1, 1, 1); PG8_STAGE(PG8_SB(1, 0), b3, voffB);
            PG8_BAR; PG8_WAIT_L(0); PG8_MMA(0, 1, At, B1); PG8_BAR;
            PG8_LDA(At, 1, 1); PG8_STAGE(PG8_SA(1, 0), a3, voffA);
            PG8_BAR; PG8_WAIT_L(0); PG8_MMA(1, 0, At, B0); PG8_BAR; PG8_SCHED;
            PG8_STAGE(PG8_SB(1, 1), b3 + hstepB, voffB);
            PG8_WAIT_V(6); PG8_BAR; PG8_MMA(1, 1, At, B1); PG8_BAR;
            }
        }
        if constexpr (ALIGN_EPI) { if (wr == 0) PG8_BAR; }
        if constexpr (FP8) asm volatile("s_nop 7\n\ts_nop 7" ::: "memory");
        if constexpr (!Epi::AFTER_DRAIN) { E(acc, cur, wr, wc, fr, fq); S.done(cur); }
        if (!has_next) break;
#pragma unroll
        for (int a = 0; a < 2; ++a)
#pragma unroll
            for (int b = 0; b < 2; ++b)
#pragma unroll
                for (int m = 0; m < 4; ++m)
#pragma unroll
                    for (int n = 0; n < 2; ++n) acc[a][b][m][n] = (f32x4){0.f, 0.f, 0.f, 0.f};
        cur = nxt; cA = nA; cB = nB; ++ui;
        if constexpr (ALIGN_EPI) { if (wr == 1) PG8_BAR; }
    }
    PG8_WAIT_V(0);
    if constexpr (!ALIGN_EPI) { if (wr == 0) PG8_BAR; }
    PG8_BAR;
    if constexpr (Epi::AFTER_DRAIN) { E.fused(acc, cur, wr, wc, fr, fq, lds, wid, lane); S.done(cur); }
#undef PG8_SA
#undef PG8_SB
#undef PG8_STAGE
#undef PG8_LDA
#undef PG8_LDB
#undef PG8_MMA
#undef PG8_WAIT_V
#undef PG8_WAIT_L
#undef PG8_BAR
#undef PG8_SCHED
}
template <class Epi, class Sched, bool FP8 = false>
__device__ __forceinline__ void gemm_phase_gather(PG8_LAS unsigned char* lds, const Gemm g, const Sched& S, const Epi& E) {
    const int tid = threadIdx.x, wid = __builtin_amdgcn_readfirstlane(tid >> 6), lane = tid & 63, wr = wid >> 2, wc = wid & 3, fr = lane & 15, fq = lane >> 4;
    const int K = g.K, nt = K / BK;
    unsigned voffB[2]; int RA[2], CA[2];
#pragma unroll
    for (int i = 0; i < 2; ++i) { int R, C; stage_rc(tid * 16 + i * 8192, R, C); const int Rb = Epi::PERM ? ((R & ~31) + perm32(R & 31)) : R;
        RA[i] = R; CA[i] = C; voffB[i] = (unsigned)(Rb * g.ldb + C) * 2u; }
    const size_t kstep = (size_t)(BK * 2);
    const size_t hstepB = (size_t)HALF * g.ldb * 2, tstepB = 2 * hstepB;
    const unsigned ldsw = (unsigned)wid * 1024u;
    const int aoff = lds_byte(wr * 64 + fr, fq * 8), boff = lds_byte(wc * 32 + fr, fq * 8);
#define PG8_SA(b, h) (((b) * 2 + (h)) * HTB)
#define PG8_SB(b, h) ((4 + (b) * 2 + (h)) * HTB)
#define PG8_STAGE(bufoff, gbase, voff) do { _Pragma("unroll") for (int _i = 0; _i < 2; ++_i) \
        __builtin_amdgcn_global_load_lds((const unsigned*)((const char*)(gbase) + (voff)[_i]), (PG8_LAS unsigned*)(lds + (bufoff) + ldsw + _i * 8192), 16, 0, 0); } while (0)
#define PG8_LDA(dst, b, h) do { _Pragma("unroll") for (int m = 0; m < 4; ++m) { if constexpr (FP8) dst##8[m] = cat8(*(const PG8_LAS bf16x8*)(lds + PG8_SA(b, h) + aoff + m * 2048), *(const PG8_LAS bf16x8*)(lds + PG8_SA(b, h) + aoff + m * 2048 + 1024)); \
        else { _Pragma("unroll") for (int k = 0; k < 2; ++k) dst[m][k] = *(const PG8_LAS bf16x8*)(lds + PG8_SA(b, h) + aoff + m * 2048 + k * 1024); } } } while (0)
#define PG8_LDB(dst, b, h) do { _Pragma("unroll") for (int n = 0; n < 2; ++n) { if constexpr (FP8) dst##8[n] = cat8(*(const PG8_LAS bf16x8*)(lds + PG8_SB(b, h) + boff + n * 2048), *(const PG8_LAS bf16x8*)(lds + PG8_SB(b, h) + boff + n * 2048 + 1024)); \
        else { _Pragma("unroll") for (int k = 0; k < 2; ++k) dst[n][k] = *(const PG8_LAS bf16x8*)(lds + PG8_SB(b, h) + boff + n * 2048 + k * 1024); } } } while (0)
#define PG8_MMA(ai, bj, At, Bt) do { __builtin_amdgcn_s_setprio(1); _Pragma("unroll") for (int m = 0; m < 4; ++m) _Pragma("unroll") for (int n = 0; n < 2; ++n) { \
        if constexpr (FP8) asm volatile("v_mfma_scale_f32_16x16x128_f8f6f4 %0, %1, %2, %0, %3, %3 op_sel_hi:[0,0,0]" : "+v"(acc[ai][bj][m][n]) : "v"(Bt##8[n]), "v"(At##8[m]), "v"(fp8_unit_scale)); \
        else { _Pragma("unroll") for (int k = 0; k < 2; ++k) acc[ai][bj][m][n] = __builtin_amdgcn_mfma_f32_16x16x32_bf16(Bt[n][k], At[m][k], acc[ai][bj][m][n], 0, 0, 0); } } __builtin_amdgcn_s_setprio(0); } while (0)
#define PG8_WAIT_V(n) asm volatile("s_waitcnt vmcnt(" #n ")" ::: "memory")
#define PG8_WAIT_L(n) asm volatile("s_waitcnt lgkmcnt(" #n ")" ::: "memory")
#define PG8_BAR __builtin_amdgcn_s_barrier()
#define PG8_SCHED __builtin_amdgcn_sched_barrier(0)
#define PG8_ROWS(dst, ui_) do { _Pragma("unroll") for (int _h = 0; _h < 2; ++_h) _Pragma("unroll") for (int _i = 0; _i < 2; ++_i) \
        dst[_h][_i] = (unsigned)S.row_token((ui_), _h * HALF + RA[_i]) * (unsigned)(g.lda * 2) + (unsigned)(CA[_i] * 2); } while (0)
    Unit cur, nxt; int ui = 0;
    if (!S.next(0, cur)) return;
    f32x4 acc[2][2][4][2];
#pragma unroll
    for (int a = 0; a < 2; ++a)
#pragma unroll
        for (int b = 0; b < 2; ++b)
#pragma unroll
            for (int m = 0; m < 4; ++m)
#pragma unroll
                for (int n = 0; n < 2; ++n) acc[a][b][m][n] = (f32x4){0.f, 0.f, 0.f, 0.f};
    int fp8_unit_scale = 0x7F7F7F7F; asm volatile("" : "+v"(fp8_unit_scale));
    bf16x8 At[4][2], B0[2][2], B1[2][2];
    i32x8 At8[4], B08[2], B18[2];
    unsigned offC[2][2];
    PG8_ROWS(offC, 0);
    const char* gA = (const char*)g.A;
    const char* cB = (const char*)g.Bt + (size_t)cur.pn * tstepB;
    PG8_STAGE(PG8_SB(0, 0), cB, voffB); PG8_STAGE(PG8_SB(0, 1), cB + hstepB, voffB); PG8_STAGE(PG8_SA(0, 0), gA, offC[0]); PG8_STAGE(PG8_SA(0, 1), gA, offC[1]);
    if (wr == 1) PG8_BAR;
    PG8_WAIT_V(2); PG8_BAR;
    PG8_STAGE(PG8_SB(1, 0), cB + kstep, voffB); PG8_STAGE(PG8_SA(1, 0), gA + kstep, offC[0]); PG8_STAGE(PG8_SB(1, 1), cB + hstepB + kstep, voffB);
    PG8_WAIT_V(6); PG8_BAR;
    for (;;) {
        const bool has_next = S.next(ui + 1, nxt);
        const char* nB = has_next ? (const char*)g.Bt + (size_t)nxt.pn * tstepB : cB;
        for (int t = 0; t < nt; t += 2) {
            const bool last = (t == nt - 2);
            const char* a1 = gA + (size_t)(t + 1) * kstep;
            const char* a2 = last ? gA : gA + (size_t)(t + 2) * kstep; const char* b2 = last ? nB : cB + (size_t)(t + 2) * kstep;
            const char* a3 = a2 + kstep; const char* b3 = b2 + kstep;
            PG8_LDB(B0, 0, 0); PG8_LDB(B1, 0, 1); PG8_SCHED; PG8_LDA(At, 0, 0); PG8_STAGE(PG8_SA(1, 1), a1, offC[1]);
            if (last && has_next) { PG8_ROWS(offC, ui + 1); }
            PG8_WAIT_V(8); PG8_WAIT_L(0); PG8_BAR; PG8_MMA(0, 0, At, B0); PG8_MMA(0, 1, At, B1); PG8_BAR; PG8_SCHED;
            PG8_LDA(At, 0, 1); PG8_STAGE(PG8_SB(0, 0), b2, voffB); PG8_STAGE(PG8_SB(0, 1), b2 + hstepB, voffB); PG8_STAGE(PG8_SA(0, 0), a2, offC[0]);
            PG8_WAIT_V(8); PG8_WAIT_L(0); PG8_BAR; PG8_MMA(1, 0, At, B0); PG8_MMA(1, 1, At, B1); PG8_BAR; PG8_SCHED;
            PG8_LDB(B0, 1, 0); PG8_LDB(B1, 1, 1); PG8_SCHED; PG8_LDA(At, 1, 0); PG8_STAGE(PG8_SA(0, 1), a2, offC[1]);
            PG8_WAIT_V(8); PG8_WAIT_L(0); PG8_BAR; PG8_MMA(0, 0, At, B0); PG8_MMA(0, 1, At, B1); PG8_BAR; PG8_SCHED;
            PG8_LDA(At, 1, 1); PG8_STAGE(PG8_SB(1, 0), b3, voffB); PG8_STAGE(PG8_SB(1, 1), b3 + hstepB, voffB); PG8_STAGE(PG8_SA(1, 0), a3, offC[0]);
            PG8_WAIT_V(8); PG8_WAIT_L(0); PG8_BAR; PG8_MMA(1, 0, At, B0); PG8_MMA(1, 1, At, B1); PG8_BAR; PG8_SCHED;
        }
        if (wr == 0) PG8_BAR;
        if constexpr (FP8) asm volatile("s_nop 7\n\ts_nop 7" ::: "memory");
        E(acc, cur, wr, wc, fr, fq); S.done(cur);
        if (!has_next) break;
#pragma unroll
        for (int a = 0; a < 2; ++a)
#pragma unroll
            for (int b = 0; b < 2; ++b)
#pragma unroll
                for (int m = 0; m < 4; ++m)
#pragma unroll
                    for (int n = 0; n < 2; ++n) acc[a][b][m][n] = (f32x4){0.f, 0.f, 0.f, 0.f};
        cur = nxt; cB = nB; ++ui;
        if (wr == 1) PG8_BAR;
    }
    PG8_WAIT_V(0);
    PG8_BAR;
#undef PG8_ROWS
#undef PG8_SA
#undef PG8_SB
#undef PG8_STAGE
#undef PG8_LDA
#undef PG8_LDB
#undef PG8_MMA
#undef PG8_WAIT_V
#undef PG8_WAIT_L
#undef PG8_BAR
#undef PG8_SCHED
}
}

#ifndef CONV_SKIP
#define CONV_SKIP 6
#endif
#ifndef MERGE_FP8
#define MERGE_FP8 1
#endif
#ifndef MOE_DN_FP8
#define MOE_DN_FP8 1
#endif
#ifndef MOE_UP_FP8
#define MOE_UP_FP8 1
#endif
#ifndef PROBE_NOATOM
#define PROBE_NOATOM 0
#endif
constexpr int T = 8192, D = 2048, NL = 2, BW = 512, ZC = 14336, INC = 14352;
constexpr int NE = 64, NEX = 65  , ED = 512;
constexpr int BRW = 4 * BW;
constexpr int HK = NEX * ED;
constexpr float ALPHA = 1.41421356237f;
constexpr float LN_EPS = 1e-5f;
constexpr float UPSC = MOE_UP_FP8 ? (1.f / 64.f) : 1.f;
constexpr float BRSC = MERGE_FP8 ? 8.f : 1.f, MGSC = MERGE_FP8 ? (1.f / (8.f * 64.f)) : 1.f;
constexpr float HSC = 8.f, DNSC = MOE_DN_FP8 ? (1.f / (HSC * 64.f)) : 1.f;
constexpr int ZC_SBQ = 0, ZC_SBK = 512, ZC_SBV = 1024, ZC_GMU = 1536, ZC_GMV = 2048, ZC_GDN = 2560, ZC_GDNG = 4096,
              ZC_MLQ = 4608, ZC_MLK = 4864, ZC_MLV = 5120, ZC_MLO = 5632, ZC_GATE = 6144;

#define GAS __attribute__((address_space(1)))
#define LAS __attribute__((address_space(3)))
typedef unsigned short bf16;
typedef unsigned v4u __attribute__((ext_vector_type(4)));
typedef unsigned v2u __attribute__((ext_vector_type(2)));
typedef float v4f __attribute__((ext_vector_type(4)));
typedef float v2f __attribute__((ext_vector_type(2)));
#define LDS_WAIT() asm volatile("s_waitcnt lgkmcnt(0)" ::: "memory")
#define LDS_BAR() do { asm volatile("s_waitcnt lgkmcnt(0)" ::: "memory"); __builtin_amdgcn_s_barrier(); asm volatile("" ::: "memory"); } while (0)

constexpr size_t MiB = 1u << 20;
constexpr size_t WS_CTL = 0, CTL_ZERO_BYTES = 1 * MiB;
constexpr size_t WS_WIN = 2 * MiB, WS_WBR = 58 * MiB, WS_WOUT = 66 * MiB, WS_WUP = 74 * MiB, WS_WDN = 334 * MiB;
constexpr size_t WS_XB = 464 * MiB, WS_SMALL = 496 * MiB, WS_EG = 497 * MiB, WS_BETA = WS_EG + 256 * 1024, WS_COMB = 498 * MiB;
constexpr size_t WS_Z = 500 * MiB, WS_GQ = 724 * MiB, WS_GK = 740 * MiB, WS_GV = 756 * MiB, WS_GO = 772 * MiB, WS_HO = 788 * MiB;
constexpr size_t WS_BR = 804 * MiB, WS_MTMP = 836 * MiB, WS_MSUM = 900 * MiB, WS_Y = 932 * MiB, WS_X1 = 996 * MiB, WS_X1B = 1060 * MiB;
constexpr size_t WS_XCUR = 1092 * MiB, WS_HB = 1156 * MiB, WS_YEXP = 1236 * MiB, WS_LIST = 1524 * MiB, WS_WL = 1526 * MiB, WS_SLOT = 1528 * MiB, WS_MQ = 1530 * MiB, WS_MS = 1534 * MiB, WS_MK = 1538 * MiB, WS_MV = 1542 * MiB, WS_MFL = 1552 * MiB, WS_HDEN = WS_MFL + 65536, WS_VT = 1553 * MiB, WS_END = 1561 * MiB;
constexpr size_t WS_GU = WS_GQ, WS_GNW = WS_GK, WS_GQG = WS_GK + 8 * MiB, WS_GKT = WS_GV, WS_GAT = WS_GV + 8 * MiB, WS_GDL = WS_GV + 12 * MiB;
constexpr int HROWS = 73728;
static_assert(WS_HB + (size_t)HROWS * ED * 2 <= WS_YEXP && WS_YEXP + (size_t)HROWS * D * 2 <= WS_LIST, "ws map (moe)");
static_assert(WS_WIN + (size_t)ZC * D * 2 <= WS_WBR && WS_WUP + (size_t)NEX * 1024 * D * 2 <= WS_WDN && WS_WDN + (size_t)D * HK * 2 <= WS_XB, "ws map (weights)");
static_assert(WS_Z + (size_t)T * ZC * 2 <= WS_GQ, "ws map (acts)");
constexpr int CW_BAR = 4096, CW_CNT = 16384;
constexpr int TAB_OFF = 131072 + 1024;
constexpr int LDS_BYTES = 163840, MISC_OFF = 131072 + 320;

__device__ __forceinline__ float bflo(unsigned w) { return __uint_as_float(w << 16); }
__device__ __forceinline__ float bfhi(unsigned w) { return __uint_as_float(w & 0xffff0000u); }
__device__ __forceinline__ unsigned f2bf(float f) { unsigned u = __float_as_uint(f); return (u + 0x7fffu + ((u >> 16) & 1u)) >> 16; }
typedef __bf16 bf16n2 __attribute__((ext_vector_type(2))); typedef float f32n2 __attribute__((ext_vector_type(2)));
__device__ __forceinline__ unsigned pk2(float lo, float hi) { const bf16n2 v = __builtin_convertvector((f32n2){lo, hi}, bf16n2); return __builtin_bit_cast(unsigned, v); }
__device__ __forceinline__ unsigned pk4_f8(float a, float b, float c, float d, float sc) {
    a = __builtin_amdgcn_fmed3f(a * sc, -448.f, 448.f); b = __builtin_amdgcn_fmed3f(b * sc, -448.f, 448.f); c = __builtin_amdgcn_fmed3f(c * sc, -448.f, 448.f); d = __builtin_amdgcn_fmed3f(d * sc, -448.f, 448.f);
    unsigned w = 0; w = __builtin_amdgcn_cvt_pk_fp8_f32(a, b, w, false); w = __builtin_amdgcn_cvt_pk_fp8_f32(c, d, w, true); return w; }
__device__ __forceinline__ v4f ld4(const void* base, size_t idx, bool is_bf16) {
    if (is_bf16) { const v2u r = *(const v2u*)((const unsigned short*)base + idx); return (v4f){bflo(r.x), bfhi(r.x), bflo(r.y), bfhi(r.y)}; }
    return *(const v4f*)((const float*)base + idx); }
template <int CTRL> __device__ __forceinline__ float dpp(float x) { return __builtin_bit_cast(float, __builtin_amdgcn_mov_dpp(__builtin_bit_cast(int, x), CTRL, 0xf, 0xf, true)); }
__device__ __forceinline__ float sum4(float x) { x += dpp<0xB1>(x); x += dpp<0x4E>(x); return x; }
__device__ __forceinline__ float sum8(float x) { x = sum4(x); x += dpp<0x141>(x); return x; }
__device__ __forceinline__ float sum16(float x) { x = sum8(x); x += dpp<0x140>(x); return x; }
__device__ __forceinline__ float wave_sum(float x) { x = sum16(x); x += __shfl_xor(x, 16); x += __shfl_xor(x, 32); return x; }
__device__ __forceinline__ float max8(float x) { x = fmaxf(x, dpp<0xB1>(x)); x = fmaxf(x, dpp<0x4E>(x)); x = fmaxf(x, dpp<0x141>(x)); return x; }
__device__ __forceinline__ float min8(float x) { x = fminf(x, dpp<0xB1>(x)); x = fminf(x, dpp<0x4E>(x)); x = fminf(x, dpp<0x141>(x)); return x; }
__device__ __forceinline__ float wave_scan_incl(float v) {
    v += __builtin_bit_cast(float, __builtin_amdgcn_update_dpp(0, __builtin_bit_cast(int, v), 0x111, 0xf, 0xf, true));
    v += __builtin_bit_cast(float, __builtin_amdgcn_update_dpp(0, __builtin_bit_cast(int, v), 0x112, 0xf, 0xf, true));
    v += __builtin_bit_cast(float, __builtin_amdgcn_update_dpp(0, __builtin_bit_cast(int, v), 0x114, 0xf, 0xf, true));
    v += __builtin_bit_cast(float, __builtin_amdgcn_update_dpp(0, __builtin_bit_cast(int, v), 0x118, 0xf, 0xf, true));
    v += __builtin_bit_cast(float, __builtin_amdgcn_update_dpp(0, __builtin_bit_cast(int, v), 0x142, 0xa, 0xf, false));
    v += __builtin_bit_cast(float, __builtin_amdgcn_update_dpp(0, __builtin_bit_cast(int, v), 0x143, 0xc, 0xf, false));
    return v;
}
__device__ __forceinline__ float sigmoidf_(float x) { return __builtin_amdgcn_rcpf(1.f + __expf(-x)); }
__device__ __forceinline__ float sigmoid_div(float x) { return 1.f / (1.f + __expf(-x)); }
__device__ __forceinline__ float siluf_(float x) { return x * __builtin_amdgcn_rcpf(1.f + __expf(-x)); }
__device__ __forceinline__ float softplusf_(float x) { return fmaxf(x, 0.f) + __logf(1.f + __expf(-fabsf(x))); }
__device__ __forceinline__ float gelu_tanh(float x) { const float y = 0.7978845608f * (x + 0.044715f * x * x * x); const float t = 1.f - 2.f * __builtin_amdgcn_rcpf(__expf(2.f * y) + 1.f); return 0.5f * x * (1.f + t); }
__device__ __forceinline__ void unpack8(const v4u r, float (&f)[8]) { f[0] = bflo(r.x); f[1] = bfhi(r.x); f[2] = bflo(r.y); f[3] = bfhi(r.y); f[4] = bflo(r.z); f[5] = bfhi(r.z); f[6] = bflo(r.w); f[7] = bfhi(r.w); }
#define XB_TMO      128
#define XB_XCNT(j)  (256  + 64 * (j))
#define XB_XSUB(j)  (1280 + 64 * (j))
#define XB_XGEN(j)  (2304 + 64 * (j))
#define XB_TOP      3328
#define XB_TOPGEN   3392
#define XCD_BAR_WORDS 3456
#define XB_SPIN_CAP (1u << 18)

__device__ __forceinline__ unsigned xb_ld(unsigned* p)              { return __hip_atomic_load(p, __ATOMIC_RELAXED, __HIP_MEMORY_SCOPE_AGENT); }
__device__ __forceinline__ unsigned xb_add(unsigned* p, unsigned v) { return __hip_atomic_fetch_add(p, v, __ATOMIC_RELAXED, __HIP_MEMORY_SCOPE_AGENT); }
__device__ __forceinline__ unsigned xb_xcc_id() { return (unsigned)__builtin_amdgcn_s_getreg((3 << 11) | 20) & 0xFu; }
#define XB_SPIN(cond, bar) do { unsigned _sp = 0; while (cond) { __builtin_amdgcn_s_sleep(1); \
    if ((++_sp & 255u) == 0u) { if (xb_ld(&(bar)[XB_TMO])) break; if (_sp > XB_SPIN_CAP) { atomicAdd(&(bar)[XB_TMO], 1u); break; } } } } while (0)

struct XcdBarrier {
    unsigned* bar; unsigned x;
    volatile LAS unsigned* st;
};

__device__ __forceinline__ XcdBarrier xcd_barrier_post(unsigned* bar, volatile LAS unsigned* st) {
    XcdBarrier b; b.bar = bar; b.x = xb_xcc_id(); b.st = st;
    if (threadIdx.x == 0) (void)xb_add(&bar[XB_XCNT(b.x)], 1u);
    return b;
}
__device__ __forceinline__ void xcd_barrier_complete(unsigned* bar, unsigned x, unsigned& nloc, unsigned& nx) {
    const unsigned G = gridDim.x * gridDim.y * gridDim.z;
    unsigned sum, cnt, mine, sp = 0u;
    for (;;) {
        sum = 0u; cnt = 0u; mine = 0u;
#pragma unroll
        for (unsigned j = 0; j < 16; ++j) { const unsigned c = xb_ld(&bar[XB_XCNT(j)]); sum += c; cnt += (c > 0u) ? 1u : 0u; mine = (j == x) ? c : mine; }
        if (sum == G) break;
        __builtin_amdgcn_s_sleep(1);
        if ((++sp & 255u) == 0u) { if (xb_ld(&bar[XB_TMO])) break; if (sp > XB_SPIN_CAP) { atomicAdd(&bar[XB_TMO], 1u); break; } }
    }
    nloc = mine > 0u ? mine : 1u; nx = cnt > 0u ? cnt : 1u;
}

__device__ __forceinline__ void xcd_barrier(const XcdBarrier& b) {
    asm volatile("s_waitcnt vmcnt(0)" ::: "memory");
    __syncthreads();
    if (threadIdx.x == 0) {
        unsigned* bar = b.bar;
        __builtin_amdgcn_s_waitcnt(0);
        unsigned nloc = b.st[0], nx = b.st[1];
        if (nloc == 0u) { xcd_barrier_complete(bar, b.x, nloc, nx); b.st[0] = nloc; b.st[1] = nx; }
        const unsigned old = xb_add(&bar[XB_XSUB(b.x)], 1u);
        const unsigned gen = old / nloc;
        if (old + 1u == (gen + 1u) * nloc) {
            __builtin_amdgcn_fence(__ATOMIC_RELEASE, "agent");
            asm volatile("s_waitcnt vmcnt(0)" ::: "memory");
            const unsigned og = xb_add(&bar[XB_TOP], 1u);
            const unsigned tg = og / nx;
            if (og + 1u == (tg + 1u) * nx) xb_add(&bar[XB_TOPGEN], 1u);
            else XB_SPIN(xb_ld(&bar[XB_TOPGEN]) == tg, bar);
            __builtin_amdgcn_fence(__ATOMIC_ACQUIRE, "agent");
            xb_add(&bar[XB_XGEN(b.x)], 1u);
            asm volatile("s_waitcnt vmcnt(0)" ::: "memory");
        } else {
            XB_SPIN(xb_ld(&bar[XB_XGEN(b.x)]) == gen, bar);
            __builtin_amdgcn_fence(__ATOMIC_ACQUIRE, "agent");
            asm volatile("s_waitcnt vmcnt(0)" ::: "memory");
        }
    }
    __syncthreads();
}

struct Params { const float* in[27]; float* out; unsigned char* ws; int ph_lo, ph_hi; };
enum { I_X = 0, I_WIN, I_GMNG, I_GMNB, I_GMWS, I_GMBS, I_CONVW, I_ALOG, I_DTB, I_GDNNG, I_MLIB, I_MLFB, I_MLNG, I_WBR, I_WOUT, I_LN1G, I_LN1B,
       I_WR, I_RB, I_WG, I_WU, I_WD, I_SG, I_SU, I_SD, I_LN2G, I_LN2B };

using pg8::f32x4; using pg8::u32x4; using pg8::Unit; using pg8::HALF; using pg8::BM;

struct EpiMergeH {
    static constexpr bool PERM = true, AFTER_DRAIN = false; static constexpr int MID = MERGE_FP8 ? BW / (2 * pg8::BK) : BW / pg8::BK;
    const bf16* Z; bf16* msum;
    __device__ __forceinline__ void mid(f32x4 (&acc)[2][2][4][2], const Unit& u, int j, int wr, int wc, int fr, int fq) const {
        int row0 = u.pm * BM + wr * 64 + fr; const int col0 = u.pn * BM + wc * 32 + 8 * fq; asm volatile("" : "+v"(row0));
        const bf16* zp = Z + ZC_GATE + (size_t)(j - 1) * D + col0;
#pragma unroll
        for (int am = 0; am < 4; ++am) { const int ai = am >> 1, m0 = (am & 1) * 2; v4u ga[2][2], gb[2][2];
#pragma unroll
            for (int m = 0; m < 2; ++m)
#pragma unroll
                for (int bj = 0; bj < 2; ++bj) { const bf16* q = zp + (size_t)(row0 + ai * HALF + (m0 + m) * 16) * ZC + bj * HALF; ga[m][bj] = *(const v4u*)q; gb[m][bj] = *(const v4u*)(q + D); }
#pragma unroll
            for (int m = 0; m < 2; ++m)
#pragma unroll
                for (int bj = 0; bj < 2; ++bj) { float a[8], b[8]; unpack8(ga[m][bj], a); unpack8(gb[m][bj], b);
#pragma unroll
                    for (int i = 0; i < 8; ++i) { const float ea = __builtin_amdgcn_exp2f(fmaxf(a[i], -60.f) * -1.44269504f), eb = __builtin_amdgcn_exp2f(fmaxf(b[i], -60.f) * -1.44269504f);
                        acc[ai][bj][m0 + m][i >> 2][i & 3] *= (1.f + eb) * __builtin_amdgcn_rcpf(1.f + ea); } }
            asm volatile("" ::: "memory"); }
    }
    __device__ __forceinline__ void operator()(const f32x4 (&acc)[2][2][4][2], const Unit& u, int wr, int wc, int fr, int fq) const {
        const int row0 = u.pm * BM + wr * 64 + fr, col0 = u.pn * BM + wc * 32 + 8 * fq;
#pragma unroll
        for (int ai = 0; ai < 2; ++ai) { v4u gg[4][2];
#pragma unroll
            for (int m = 0; m < 4; ++m)
#pragma unroll
                for (int bj = 0; bj < 2; ++bj) gg[m][bj] = *(const v4u*)(Z + (size_t)(row0 + ai * HALF + m * 16) * ZC + ZC_GATE + 3 * D + col0 + bj * HALF);
#pragma unroll
            for (int m = 0; m < 4; ++m)
#pragma unroll
                for (int bj = 0; bj < 2; ++bj) { const size_t row = (size_t)(row0 + ai * HALF + m * 16); const int col = col0 + bj * HALF; float gl[8]; unpack8(gg[m][bj], gl);
                    f32x4 v0 = acc[ai][bj][m][0], v1 = acc[ai][bj][m][1];
#pragma unroll
                    for (int j = 0; j < 4; ++j) { v0[j] *= sigmoidf_(gl[j]) * MGSC; v1[j] *= sigmoidf_(gl[4 + j]) * MGSC; }
                    unsigned w0 = 0, w1 = 0; w0 = __builtin_amdgcn_cvt_pk_fp8_f32(v0[0], v0[1], w0, false); w0 = __builtin_amdgcn_cvt_pk_fp8_f32(v0[2], v0[3], w0, true); w1 = __builtin_amdgcn_cvt_pk_fp8_f32(v1[0], v1[1], w1, false); w1 = __builtin_amdgcn_cvt_pk_fp8_f32(v1[2], v1[3], w1, true);
                    *(v2u*)((unsigned char*)msum + row * D + col) = (v2u){w0, w1}; }
            asm volatile("" ::: "memory"); }
    }
};
struct EpiResid {
    static constexpr bool PERM = true, AFTER_DRAIN = false; static constexpr int MID = 0;
    const void* X; bf16* Y; float sc; bool xbf;
    __device__ __forceinline__ void operator()(const f32x4 (&acc)[2][2][4][2], const Unit& u, int wr, int wc, int fr, int fq) const {
        const int row0 = u.pm * BM + wr * 64 + fr, col0 = u.pn * BM + wc * 32 + 8 * fq;
#pragma unroll
        for (int ai = 0; ai < 2; ++ai)
#pragma unroll
            for (int m = 0; m < 4; ++m) { const size_t off = (size_t)(row0 + ai * HALF + m * 16) * D + col0;
#pragma unroll
                for (int bj = 0; bj < 2; ++bj) { const f32x4 x0 = ld4(X, off + bj * HALF, xbf), x1 = ld4(X, off + bj * HALF + 4, xbf);
                    const f32x4 v0 = x0 * ALPHA + acc[ai][bj][m][0] * sc, v1 = x1 * ALPHA + acc[ai][bj][m][1] * sc;
                    u32x4 w; w.x = pk2(v0[0], v0[1]); w.y = pk2(v0[2], v0[3]); w.z = pk2(v1[0], v1[1]); w.w = pk2(v1[2], v1[3]); *(u32x4*)(Y + off + bj * HALF) = w; } }
    }
};
struct MoeTab {
    LAS int* t; LAS unsigned short* tok; LAS float* wt; LAS unsigned char* mte;
    __device__ __forceinline__ MoeTab(LAS unsigned char* lds) : t((LAS int*)(lds + TAB_OFF)), tok((LAS unsigned short*)(lds + TAB_OFF + 1024)), wt((LAS float*)(lds + TAB_OFF + 5120)), mte((LAS unsigned char*)(lds + TAB_OFF + 13312)) {}
};
__device__ __forceinline__ void moe_tables(const MoeTab& M, const unsigned* cnt  , int tid, int lane, int wave) {
    __syncthreads();
    if (wave == 0) { const int c = (int)cnt[64 * lane]; const int tiles = (c + 255) >> 8; const float incl = wave_scan_incl((float)tiles);
        M.t[80 + lane] = c; M.t[lane] = (int)incl - tiles; if (lane == 63) { M.t[64] = (int)incl; M.t[65] = (int)incl + T / 256; M.t[80 + 64] = T; } }
    __syncthreads();
    const int Mt = M.t[65];
    for (int mt = tid; mt < Mt; mt += 512) { int e = 0;
        for (int k = 1; k <= 64; ++k) e = (M.t[k] <= mt) ? k : e;
        M.mte[mt] = (unsigned char)e; }
    __syncthreads();
}
struct UpOrder {
    MoeTab M; int n;
    __device__ __forceinline__ bool next(int i, Unit& u) const { if (i >= n) return false; u.pm = M.t[168 + i]; u.pn = M.t[176 + i]; u.aux = i; return true; }
    __device__ __forceinline__ int row_token(int i, int r) const { return (int)M.tok[i * 256 + r]; }
    __device__ __forceinline__ void a_ready(const Unit&) const {}
    __device__ __forceinline__ void done(const Unit&) const {}
};
__device__ __forceinline__ int up_order_build(const MoeTab& M, const int* LIST, const float* WL, int wg, int G, int tid) {
    const int U = 4 * M.t[65];
    if (tid < 8) { const int L = tid * G + wg; if (L < U) { const int mt = L >> 2, q = L & 3, e = M.mte[mt]; M.t[168 + tid] = mt; M.t[176 + tid] = e * 4 + q; M.t[184 + tid] = e; M.t[192 + tid] = mt - M.t[e]; } }
    int n = 0;
#pragma unroll
    for (int i = 0; i < 8; ++i) n += (i * G + wg < U) ? 1 : 0;
    __syncthreads();
    for (int idx = tid; idx < n * 256; idx += 512) { const int i = idx >> 8, r = idx & 255, e = M.t[184 + i], li = M.t[192 + i] * 256 + r;
        int tk = 0; float w = 0.f;
        if (e < NE) { if (li < M.t[80 + e]) { tk = LIST[e * T + li]; w = WL[e * T + li]; } } else { tk = li; w = 1.f; }
        M.tok[idx] = (unsigned short)tk; M.wt[idx] = w; }
    __syncthreads();
    return n;
}
struct EpiGluSparse {
    static constexpr bool PERM = true, AFTER_DRAIN = false; static constexpr int MID = 0;
    LAS const float* wt; bf16* H;
    __device__ __forceinline__ void operator()(const f32x4 (&acc)[2][2][4][2], const Unit& u, int wr, int wc, int fr, int fq) const {
        const int q = u.pn & 3; const int rl0 = wr * 64 + fr, col0 = q * 128 + wc * 32 + 8 * fq;
#pragma unroll
        for (int ai = 0; ai < 2; ++ai)
#pragma unroll
            for (int m = 0; m < 4; ++m) { const int rl = rl0 + ai * HALF + m * 16; const float c = wt[u.aux * 256 + rl]; float h[8];
#pragma unroll
                for (int n = 0; n < 2; ++n)
#pragma unroll
                    for (int j = 0; j < 4; ++j) h[4 * n + j] = siluf_(acc[ai][0][m][n][j] * UPSC) * (acc[ai][1][m][n][j] * UPSC) * c;
#if MOE_DN_FP8
#pragma unroll
                for (int j = 0; j < 8; ++j) h[j] = __builtin_amdgcn_fmed3f(h[j] * HSC, -448.f, 448.f);
                unsigned w0 = 0, w1 = 0; w0 = __builtin_amdgcn_cvt_pk_fp8_f32(h[0], h[1], w0, false); w0 = __builtin_amdgcn_cvt_pk_fp8_f32(h[2], h[3], w0, true); w1 = __builtin_amdgcn_cvt_pk_fp8_f32(h[4], h[5], w1, false); w1 = __builtin_amdgcn_cvt_pk_fp8_f32(h[6], h[7], w1, true);
                *(v2u*)((unsigned char*)H + ((size_t)u.pm * 256 + rl) * ED + col0) = (v2u){w0, w1}; }
#else
                u32x4 w; w.x = pk2(h[0], h[1]); w.y = pk2(h[2], h[3]); w.z = pk2(h[4], h[5]); w.w = pk2(h[6], h[7]);
                *(u32x4*)(H + ((size_t)u.pm * 256 + rl) * ED + col0) = w; }
#endif
    }
};
struct DownOrder {
    MoeTab M; int G, c, U;
    __device__ __forceinline__ bool next(int i, Unit& u) const { const int L = i * G + c; if (L >= U) return false; const int mt = L >> 3, e = (int)M.mte[mt]; u.pm = mt; u.pn = e * 8 + (L & 7); const int left = M.t[80 + e] - 256 * (mt - M.t[e]); u.aux = left < 256 ? left : 256; return true; }
    __device__ __forceinline__ void a_ready(const Unit&) const {}
    __device__ __forceinline__ void done(const Unit&) const {}
};
struct EpiYexp {
    static constexpr bool PERM = true, AFTER_DRAIN = false; static constexpr int MID = 0;
    bf16* Y;
    __device__ __forceinline__ void operator()(const f32x4 (&acc)[2][2][4][2], const Unit& u, int wr, int wc, int fr, int fq) const {
        const int row0 = u.pm * BM + wr * 64 + fr, col0 = (u.pn & 7) * BM + wc * 32 + 8 * fq;
#pragma unroll
        for (int ai = 0; ai < 2; ++ai)
#pragma unroll
            for (int m = 0; m < 4; ++m) { bf16* rowp = Y + (size_t)(row0 + ai * HALF + m * 16) * D + col0;
                if (wr * 64 + fr + ai * HALF + m * 16 >= u.aux) continue;
#pragma unroll
                for (int bj = 0; bj < 2; ++bj) { const f32x4 v0 = acc[ai][bj][m][0] * DNSC, v1 = acc[ai][bj][m][1] * DNSC;
                    u32x4 w; w.x = pk2(v0[0], v0[1]); w.y = pk2(v0[2], v0[3]); w.z = pk2(v1[0], v1[1]); w.w = pk2(v1[2], v1[3]); *(u32x4*)(rowp + bj * HALF) = w; } }
    }
};

struct TrItem { const float* src; bf16* dst; unsigned sld, dld; int f8; };
__device__ __forceinline__ void tr_load(const TrItem& t, int lane, v4f (&v)[8]) { const int r8 = lane >> 3, c4 = lane & 7;
#pragma unroll
    for (int i = 0; i < 8; ++i) v[i] = *(const v4f*)(t.src + (size_t)(8 * i + r8) * t.sld + 4 * c4); }
__device__ __forceinline__ void tr_store(const TrItem& t, const v4f (&v)[8], LAS float* scr, int lane, bool nostore = false) {
    { const int r8 = lane >> 3, c4 = lane & 7;
#pragma unroll
      for (int i = 0; i < 8; ++i) { LAS float* d = scr + (8 * i + r8) * 33 + 4 * c4; d[0] = v[i].x; d[1] = v[i].y; d[2] = v[i].z; d[3] = v[i].w; } }
    LDS_WAIT(); asm volatile("" ::: "memory");
    if (nostore) return;
    if (t.f8) {
        const int c = lane & 3;
#pragma unroll
        for (int j = 0; j < 2; ++j) { const int n = (lane >> 2) + 16 * j; const LAS float* s = scr + (16 * c) * 33 + n; unsigned w[4];
#pragma unroll
            for (int q = 0; q < 4; ++q) { unsigned x = 0; x = __builtin_amdgcn_cvt_pk_fp8_f32(s[(4 * q) * 33] * 64.f, s[(4 * q + 1) * 33] * 64.f, x, false); x = __builtin_amdgcn_cvt_pk_fp8_f32(s[(4 * q + 2) * 33] * 64.f, s[(4 * q + 3) * 33] * 64.f, x, true); w[q] = x; }
            *(v4u*)((unsigned char*)t.dst + (size_t)n * t.dld + 16 * c) = (v4u){w[0], w[1], w[2], w[3]}; }
    } else {
        const int c = lane & 7;
#pragma unroll
        for (int j = 0; j < 4; ++j) { const int n = (lane >> 3) + 8 * j; const LAS float* s = scr + (8 * c) * 33 + n;
            v4u o; o.x = pk2(s[0 * 33], s[1 * 33]); o.y = pk2(s[2 * 33], s[3 * 33]); o.z = pk2(s[4 * 33], s[5 * 33]); o.w = pk2(s[6 * 33], s[7 * 33]);
            *(v4u*)(t.dst + (size_t)n * t.dld + 8 * c) = o; }
    }
    LDS_WAIT(); asm volatile("" ::: "memory");
}
template <int PART> __device__ __forceinline__ TrItem tr_decode(const Params& p, int l, int it) {
    unsigned char* ws = p.ws;
    constexpr int N_IN = (ZC / 32) * (D / 64), N_BR = 4 * (BW / 64) * (D / 32), N_OUT = (D / 64) * (D / 32), N_UP = NEX * 2 * (D / 64) * (ED / 32);
    int r = it; TrItem t; t.f8 = 0;
    if (PART == 0) {
        const float* w_in = p.in[I_WIN] + (size_t)l * D * INC; const float* w_br = p.in[I_WBR] + (size_t)l * 4 * BW * D; const float* w_out = p.in[I_WOUT] + (size_t)l * D * D;
        bf16* WIN = (bf16*)(ws + WS_WIN); bf16* WBR = (bf16*)(ws + WS_WBR); bf16* WOUT = (bf16*)(ws + WS_WOUT);
        if (r < N_IN) { const int kb = r / (ZC / 32), n0 = (r % (ZC / 32)) * 32, k0 = kb * 64; const int sc = n0 + (n0 >= ZC_GATE ? 16 : (n0 >= ZC_MLQ ? 8 : 0));
            t.src = w_in + (size_t)k0 * INC + sc; t.sld = INC; t.dst = (bf16*)((unsigned char*)WIN + (size_t)n0 * D + k0); t.dld = D; t.f8 = 1; return t; } r -= N_IN;
        if (r < N_BR) { const int g = r / 512, rr = r % 512, k0 = (rr / 64) * 64, n0 = (rr % 64) * 32;
            t.src = w_br + ((size_t)g * BW + k0) * D + n0; t.sld = D;
#if MERGE_FP8
            t.dst = (bf16*)((unsigned char*)WBR + (size_t)n0 * BRW + g * BW + k0); t.dld = BRW; t.f8 = 1; return t; }
#else
            t.dst = WBR + (size_t)n0 * BRW + g * BW + k0; t.dld = BRW; return t; }
#endif
        r -= N_BR;
        { const int k0 = (r / 64) * 64, n0 = (r % 64) * 32; t.src = w_out + (size_t)k0 * D + n0; t.sld = D; t.dst = (bf16*)((unsigned char*)WOUT + (size_t)n0 * D + k0); t.dld = D; t.f8 = 1; return t; }
    } else {
        const float* w_g = p.in[I_WG] + (size_t)l * NE * D * ED; const float* w_u = p.in[I_WU] + (size_t)l * NE * D * ED; const float* w_d = p.in[I_WD] + (size_t)l * NE * ED * D;
        const float* s_g = p.in[I_SG] + (size_t)l * D * ED; const float* s_u = p.in[I_SU] + (size_t)l * D * ED; const float* s_d = p.in[I_SD] + (size_t)l * ED * D;
        bf16* WUP = (bf16*)(ws + WS_WUP); bf16* WDN = (bf16*)(ws + WS_WDN);
        if (r < N_UP) { const int e = r / 1024, rr = r % 1024, mat = rr / 512, r2 = rr % 512, k0 = (r2 / 16) * 64, n0 = (r2 % 16) * 32;
            const float* sb = (e < NE) ? ((mat ? w_u : w_g) + (size_t)e * D * ED) : (mat ? s_u : s_g);
            const int drow = e * 1024 + (n0 / 128) * 256 + mat * 128 + (n0 % 128);
            t.src = sb + (size_t)k0 * ED + n0; t.sld = ED;
#if MOE_UP_FP8
            t.dst = (bf16*)((unsigned char*)WUP + (size_t)drow * D + k0); t.dld = D; t.f8 = 1; return t; }
#else
            t.dst = WUP + (size_t)drow * D + k0; t.dld = D; return t; }
#endif
        r -= N_UP;
        { const int e = r / 512, rr = r % 512, k0 = (rr / 64) * 64, n0 = (rr % 64) * 32;
            const float* sb = (e < NE) ? (w_d + (size_t)e * ED * D) : s_d;
            t.src = sb + (size_t)k0 * D + n0; t.sld = D;
#if MOE_DN_FP8
            t.dst = (bf16*)((unsigned char*)WDN + ((size_t)e * D + n0) * ED + k0); t.dld = ED; t.f8 = 1; return t; }
#else
            t.dst = WDN + ((size_t)e * D + n0) * ED + k0; t.dld = ED; return t; }
#endif
    }
}
template <int PART> __device__ __forceinline__ void phase_convert(const Params& p, int l, LAS unsigned char* lds, int gw, int NGW, int wave, int lane, bool nostore = false, int lo = 0, int hi = 1 << 30) {
    constexpr int N_IN = (ZC / 32) * (D / 64), N_BR = 4 * (BW / 64) * (D / 32), N_OUT = (D / 64) * (D / 32), N_UP = NEX * 2 * (D / 64) * (ED / 32), N_DN = NEX * (ED / 64) * (D / 32);
    constexpr int NITEMS = (PART == 0) ? (N_IN + N_BR + N_OUT) : (N_UP + N_DN);
    LAS float* scr = (LAS float*)(lds + wave * 16384);
    const int NIT = hi < NITEMS ? hi : NITEMS;
    if (lo + gw >= NIT) return;
    TrItem cur = tr_decode<PART>(p, l, lo + gw); v4f va[8], vb[8];
    tr_load(cur, lane, va);
    for (int it = lo + gw; it < NIT; it += 2 * NGW) {
        const int i1 = it + NGW, i2 = it + 2 * NGW; TrItem nx = cur;
        if (i1 < NIT) { nx = tr_decode<PART>(p, l, i1); } tr_load(nx, lane, vb);
        tr_store(cur, va, scr, lane, nostore);
        if (i1 >= NIT) break;
        cur = nx; if (i2 < NIT) { cur = tr_decode<PART>(p, l, i2); } tr_load(cur, lane, va);
        tr_store(nx, vb, scr, lane, nostore);
        if (i2 >= NIT) break;
    }
}
__device__ __forceinline__ void phase_xprep(const Params& p, int l, const void* xin, bool xbf, LAS unsigned char* lds, int gw, int NGW, int tid, int lane) {
    const float* w_in = p.in[I_WIN] + (size_t)l * D * INC;
    constexpr int XP = 2052; LAS float* xt = (LAS float*)lds; LAS float* part = (LAS float*)lds;
    const int wave = tid >> 6, n_l = lane & 15, kq = lane >> 4, wg = gw >> 3, G = NGW >> 3;
    const int colw = n_l < 8 ? 4608 + n_l : 6152 + (n_l - 8);
    float bw[64];
#pragma unroll
    for (int q = 0; q < 64; ++q) bw[q] = w_in[(size_t)(256 * wave + 16 * (q >> 2) + 4 * kq + (q & 3)) * INC + colw];
    unsigned char* XB = p.ws + WS_XB; float* SMALL = (float*)(p.ws + WS_SMALL);
    __syncthreads();
    for (int tg = wg; tg < T / 16; tg += G) {
        {   v4f va[8], vb[8]; const size_t m0 = (size_t)tg * 16 + 2 * wave;
#pragma unroll
            for (int j = 0; j < 8; ++j) { va[j] = ld4(xin, m0 * D + 4 * lane + 256 * j, xbf); vb[j] = ld4(xin, (m0 + 1) * D + 4 * lane + 256 * j, xbf); }
#pragma unroll
            for (int rr = 0; rr < 2; ++rr) { unsigned* xo = (unsigned*)(XB + (m0 + rr) * D) + lane;
#pragma unroll
                for (int j = 0; j < 8; ++j) { const v4f v = rr ? vb[j] : va[j]; unsigned w = 0; w = __builtin_amdgcn_cvt_pk_fp8_f32(v.x, v.y, w, false); w = __builtin_amdgcn_cvt_pk_fp8_f32(v.z, v.w, w, true); xo[64 * j] = w;
                    *(LAS v4f*)(xt + (2 * wave + rr) * XP + 4 * lane + 256 * j) = v; } } }
        __syncthreads();
        {   pg8::f32x4 acc[4];
#pragma unroll
            for (int i = 0; i < 4; ++i) acc[i] = (pg8::f32x4){0.f, 0.f, 0.f, 0.f};
            const LAS float* xa = xt + n_l * XP + 256 * wave + 4 * kq;
#pragma unroll
            for (int s2 = 0; s2 < 16; ++s2) { const v4f a4 = *(const LAS v4f*)(xa + 16 * s2);
                acc[0] = __builtin_amdgcn_mfma_f32_16x16x4f32(a4.x, bw[4 * s2 + 0], acc[0], 0, 0, 0); acc[1] = __builtin_amdgcn_mfma_f32_16x16x4f32(a4.y, bw[4 * s2 + 1], acc[1], 0, 0, 0);
                acc[2] = __builtin_amdgcn_mfma_f32_16x16x4f32(a4.z, bw[4 * s2 + 2], acc[2], 0, 0, 0); acc[3] = __builtin_amdgcn_mfma_f32_16x16x4f32(a4.w, bw[4 * s2 + 3], acc[3], 0, 0, 0); }
            const pg8::f32x4 tot = (acc[0] + acc[1]) + (acc[2] + acc[3]);
            __syncthreads();
#pragma unroll
            for (int j = 0; j < 4; ++j) part[(wave * 16 + 4 * kq + j) * 16 + n_l] = tot[j]; }
        __syncthreads();
        if (tid < 256) { float a = 0.f;
#pragma unroll
            for (int w = 0; w < 8; ++w) a += part[w * 256 + tid];
            SMALL[(size_t)tg * 256 + tid] = a; }
        __syncthreads();
    }
}


typedef short bf16x8_t __attribute__((ext_vector_type(8)));
__device__ __forceinline__ void ml_pre_item(const Params& p, int l, LAS unsigned char* lds, int item, int tid, int wave, int lane) {
    const int h = item & 3, n = item >> 2; const size_t t0 = (size_t)n * 64;
    const bf16* Z = (const bf16*)(p.ws + WS_Z); const float* SMALL = (const float*)(p.ws + WS_SMALL);
    bf16* MQ = (bf16*)(p.ws + WS_MQ) + (size_t)item * 4096; bf16* MS = (bf16*)(p.ws + WS_MS) + (size_t)item * 4096; bf16* MK = (bf16*)(p.ws + WS_MK) + (size_t)item * 4096;
    bf16* MV = (bf16*)(p.ws + WS_MV) + (size_t)item * 9216; float* MFL = (float*)(p.ws + WS_MFL);
    LAS float* qs = (LAS float*)lds;
    LAS float* ks = qs + 64 * 65;
    LAS float* bs = ks + 64 * 65;
    LAS unsigned short* vs = (LAS unsigned short*)(bs + 128);
    { const int tk = tid >> 3, c8 = tid & 7; float f[8];
      unpack8(*(const v4u*)(Z + (t0 + tk) * ZC + ZC_MLQ + h * 64 + 8 * c8), f);
#pragma unroll
      for (int i = 0; i < 8; ++i) qs[tk * 65 + 8 * c8 + i] = f[i];
      unpack8(*(const v4u*)(Z + (t0 + tk) * ZC + ZC_MLK + h * 64 + 8 * c8), f);
#pragma unroll
      for (int i = 0; i < 8; ++i) ks[tk * 65 + 8 * c8 + i] = f[i]; }
#pragma unroll
    for (int r = 0; r < 2; ++r) { const int idx = tid + 512 * r, tk = idx >> 4, c8 = idx & 15;
        *(LAS v4u*)(vs + tk * 136 + 8 * c8) = *(const v4u*)(Z + (t0 + tk) * ZC + ZC_MLV + h * 128 + 8 * c8); }
    if (wave == 0) { const float fp = SMALL[(t0 + lane) * 16 + 12 + h] + p.in[I_MLFB][l * 4 + h]; const float lf = -softplusf_(-fp);
        bs[lane] = wave_scan_incl(lf); bs[64 + lane] = SMALL[(t0 + lane) * 16 + 8 + h] + p.in[I_MLIB][l * 4 + h]; }
    __syncthreads();
    const float blast = bs[63];
    { const int i = tid >> 3, jb = tid & 7; const float bi = bs[i];
      { const float e = __expf(bi) * 0.125f; float o[8];
#pragma unroll
        for (int x = 0; x < 8; ++x) o[x] = qs[i * 65 + 8 * jb + x] * e;
        v4u w; w.x = pk2(o[0], o[1]); w.y = pk2(o[2], o[3]); w.z = pk2(o[4], o[5]); w.w = pk2(o[6], o[7]); *(v4u*)(MQ + i * 64 + 8 * jb) = w; }
      {
          const int ti = wave >> 1, c16 = lane & 15, g4 = lane >> 4, i2 = 16 * ti + c16; const float bi2 = bs[i2];
#define ML_F8(dst, base) do { const LAS float* _b = (base); const v4u _w = (v4u){pg8::cvt_pk_bf16(_b[0], _b[1]), pg8::cvt_pk_bf16(_b[2], _b[3]), pg8::cvt_pk_bf16(_b[4], _b[5]), pg8::cvt_pk_bf16(_b[6], _b[7])}; dst = __builtin_bit_cast(bf16x8_t, _w); } while (0)
          bf16x8_t bq[2];
#pragma unroll
          for (int s2 = 0; s2 < 2; ++s2) ML_F8(bq[s2], qs + i2 * 65 + 32 * s2 + 8 * g4);
#pragma unroll
          for (int jj = 0; jj < 2; ++jj) { const int tj = 2 * (wave & 1) + jj; v2u sw = (v2u){0u, 0u};
              if (tj <= ti) { pg8::f32x4 d = {0.f, 0.f, 0.f, 0.f};
#pragma unroll
                  for (int s2 = 0; s2 < 2; ++s2) { bf16x8_t a; ML_F8(a, ks + (16 * tj + c16) * 65 + 32 * s2 + 8 * g4); d = __builtin_amdgcn_mfma_f32_16x16x32_bf16(a, bq[s2], d, 0, 0, 0); }
                  float v4[4];
#pragma unroll
                  for (int r = 0; r < 4; ++r) { const int j = 16 * tj + 4 * g4 + r; v4[r] = (j <= i2) ? __expf(bi2 - bs[j] + bs[64 + j]) * d[r] * 0.125f : 0.f; }
                  sw = (v2u){pk2(v4[0], v4[1]), pk2(v4[2], v4[3])}; }
              *(v2u*)(MS + i2 * 64 + 16 * tj + 4 * g4) = sw; }
#undef ML_F8
      }
      { float o[8];
#pragma unroll
        for (int x = 0; x < 8; ++x) { const int j = 8 * jb + x; o[x] = ks[j * 65 + i] * __expf(blast - bs[j] + bs[64 + j]); }
        v4u w; w.x = pk2(o[0], o[1]); w.y = pk2(o[2], o[3]); w.z = pk2(o[4], o[5]); w.w = pk2(o[6], o[7]); *(v4u*)(MK + i * 64 + 8 * jb) = w; }
    }
    { const int c = tid >> 2, jq = tid & 3; unsigned w[8];
#pragma unroll
      for (int x = 0; x < 8; ++x) w[x] = (unsigned)vs[(16 * jq + 2 * x) * 136 + c] | ((unsigned)vs[(16 * jq + 2 * x + 1) * 136 + c] << 16);
      *(v4u*)(MV + c * 64 + 16 * jq) = (v4u){w[0], w[1], w[2], w[3]}; *(v4u*)(MV + c * 64 + 16 * jq + 8) = (v4u){w[4], w[5], w[6], w[7]};
      if (tid < 64) { const int c2 = 128 + (tid >> 2); const unsigned one = (c2 == 128) ? 0x3F803F80u : 0u;
          *(v4u*)(MV + c2 * 64 + 16 * jq) = (v4u){one, one, one, one}; *(v4u*)(MV + c2 * 64 + 16 * jq + 8) = (v4u){one, one, one, one}; } }
    if (tid == 0) MFL[item] = __expf(blast);
    __syncthreads();
}
struct MlFrags { bf16x8_t q[2], s[2], kt[2], vt[2]; float fl; };
__device__ __forceinline__ void ml_load(MlFrags& F, const Params& p, int item, int offA, int offV) {
    const bf16* MQ = (const bf16*)(p.ws + WS_MQ) + (size_t)item * 4096; const bf16* MS = (const bf16*)(p.ws + WS_MS) + (size_t)item * 4096; const bf16* MK = (const bf16*)(p.ws + WS_MK) + (size_t)item * 4096;
    const bf16* MV = (const bf16*)(p.ws + WS_MV) + (size_t)item * 9216;
#pragma unroll
    for (int ks = 0; ks < 2; ++ks) { F.q[ks] = *(const bf16x8_t*)(MQ + offA + 32 * ks); F.s[ks] = *(const bf16x8_t*)(MS + offA + 32 * ks); F.kt[ks] = *(const bf16x8_t*)(MK + offA + 32 * ks); F.vt[ks] = *(const bf16x8_t*)(MV + offV + 32 * ks); }
    F.fl = ((const float*)(p.ws + WS_MFL))[item];
}
__device__ __forceinline__ void ml_seq(const Params& p, LAS unsigned char* lds, int wgi, int wave, int lane) {
    const int u = wgi * 2 + (wave >> 2), wi = wave & 3, h = u / 9, sl = u % 9, g = lane >> 4, c = lane & 15;
    LAS unsigned short* CT = (LAS unsigned short*)(lds + (wave >> 2) * 4096);
    float* HO = (float*)(p.ws + WS_HO); float* HDEN = (float*)(p.ws + WS_HDEN);
    const int offA = (16 * wi + c) * 64 + 8 * g, offV = (16 * sl + c) * 64 + 8 * g;
    *(LAS v2u*)(CT + c * 64 + 16 * wi + 4 * g) = (v2u){0u, 0u};
    pg8::f32x4 Cacc = {0.f, 0.f, 0.f, 0.f};
    __syncthreads();
    MlFrags F0, F1;
    ml_load(F0, p, h, offA, offV);
#define ML_STEP(F, n_) do { const int cur = (n_) & 1; \
        const bf16x8_t c0 = *(const LAS bf16x8_t*)(CT + cur * 1024 + c * 64 + 8 * g), c1 = *(const LAS bf16x8_t*)(CT + cur * 1024 + c * 64 + 32 + 8 * g); \
        pg8::f32x4 num = {0.f, 0.f, 0.f, 0.f}; \
        num = __builtin_amdgcn_mfma_f32_16x16x32_bf16(F.q[0], c0, num, 0, 0, 0); num = __builtin_amdgcn_mfma_f32_16x16x32_bf16(F.q[1], c1, num, 0, 0, 0); \
        num = __builtin_amdgcn_mfma_f32_16x16x32_bf16(F.s[0], F.vt[0], num, 0, 0, 0); num = __builtin_amdgcn_mfma_f32_16x16x32_bf16(F.s[1], F.vt[1], num, 0, 0, 0); \
        Cacc = Cacc * F.fl; \
        Cacc = __builtin_amdgcn_mfma_f32_16x16x32_bf16(F.kt[0], F.vt[0], Cacc, 0, 0, 0); Cacc = __builtin_amdgcn_mfma_f32_16x16x32_bf16(F.kt[1], F.vt[1], Cacc, 0, 0, 0); \
        { v2u w; w.x = pk2(Cacc[0], Cacc[1]); w.y = pk2(Cacc[2], Cacc[3]); *(LAS v2u*)(CT + (cur ^ 1) * 1024 + c * 64 + 16 * wi + 4 * g) = w; } \
        { const size_t tb = (size_t)(n_) * 64 + 16 * wi + 4 * g; \
          if (sl < 8) { _Pragma("unroll") for (int r = 0; r < 4; ++r) HO[(tb + r) * BW + h * 128 + 16 * sl + c] = num[r]; } \
          else if (c == 0) { _Pragma("unroll") for (int r = 0; r < 4; ++r) HDEN[(tb + r) * 4 + h] = num[r]; } } \
        LDS_BAR(); } while (0)
    for (int n = 0; n < T / 64; n += 2) {
        ml_load(F1, p, (n + 1) * 4 + h, offA, offV);
        ML_STEP(F0, n);
        ml_load(F0, p, ((n + 2 < T / 64) ? n + 2 : n) * 4 + h, offA, offV);
        ML_STEP(F1, n + 1);
    }
#undef ML_STEP
}


constexpr int QP = 132;
__device__ __forceinline__ void gdn_pre_item(const Params& p, int l, LAS unsigned char* lds, int item, int tid, int wave, int lane) {
    const int h = item & 3, n = item >> 2; const size_t t0 = (size_t)n * 64;
    const bf16* Z = (const bf16*)(p.ws + WS_Z); const float* SMALL = (const float*)(p.ws + WS_SMALL);
    float* GU = (float*)(p.ws + WS_GU) + (size_t)item * 8192; bf16* GNW = (bf16*)(p.ws + WS_GNW) + (size_t)item * 8192; bf16* GQG = (bf16*)(p.ws + WS_GQG) + (size_t)item * 8192;
    bf16* GAT = (bf16*)(p.ws + WS_GAT) + (size_t)item * 4096; bf16* GKT = (bf16*)(p.ws + WS_GKT) + (size_t)item * 8192; float* GDL = (float*)(p.ws + WS_GDL);
    const float* cw = p.in[I_CONVW] + (size_t)l * 4 * 1536;
    LAS float* qs = (LAS float*)lds; LAS float* ks = qs + 64 * QP; LAS float* vs = ks + 64 * QP; LAS float* Ls = vs + 64 * QP;   LAS float* gcs = Ls + 64 * 68; LAS float* bts = gcs + 64; LAS float* btg = bts + 64;
    LAS unsigned short* zq = (LAS unsigned short*)(lds + 131584); LAS unsigned short* zk = (LAS unsigned short*)Ls; LAS unsigned short* zv = (LAS unsigned short*)vs; LAS float* cwl = btg + 64;
    float gate_b = 0.f, gate_a = 0.f; if (wave == 0) { gate_b = SMALL[(t0 + lane) * 16 + h]; gate_a = SMALL[(t0 + lane) * 16 + 4 + h]; }
    {   v4u zr[7]; v4f wr4 = (v4f){0.f, 0.f, 0.f, 0.f};
#pragma unroll
        for (int q = 0; q < 7; ++q) { const int idx = tid + 512 * q; zr[q] = (v4u){0u, 0u, 0u, 0u};
            if (idx < 3216) { const int seg = idx / 1072, rem = idx % 1072, r = rem >> 4, c16 = rem & 15; const long tt = (long)t0 - 3 + r;
                if (tt >= 0) zr[q] = *(const v4u*)(Z + (size_t)tt * ZC + ZC_GDN + seg * 512 + h * 128 + 8 * c16); } }
        if (tid < 384) { const int j = tid / 96, rest = tid % 96, i = rest >> 5, c4 = rest & 31; wr4 = *(const v4f*)(cw + j * 1536 + i * 512 + h * 128 + 4 * c4); }
#pragma unroll
        for (int q = 0; q < 7; ++q) { const int idx = tid + 512 * q;
            if (idx < 3216) { const int seg = idx / 1072, rem = idx % 1072; LAS unsigned short* zb = seg == 0 ? zq : (seg == 1 ? zk : zv); *(LAS v4u*)(zb + 8 * rem) = zr[q]; } }
        if (tid < 384) *(LAS v4f*)(cwl + 4 * tid) = wr4;
    }
    __syncthreads();
    { const int tk = tid >> 3, part = tid & 7; float av[16];
#pragma unroll 1
      for (int i = 0; i < 3; ++i) { float a[16]; const LAS unsigned short* zb = i == 0 ? zq : (i == 1 ? zk : zv);
#pragma unroll
        for (int x = 0; x < 16; ++x) a[x] = 0.f;
#pragma unroll
        for (int j = 0; j < 4; ++j) { const LAS unsigned short* src = zb + (tk + j) * 128 + 16 * part; float x0[8], x1[8]; unpack8(*(const LAS v4u*)src, x0); unpack8(*(const LAS v4u*)(src + 8), x1);
            const LAS float* wp = cwl + (j * 3 + i) * 128 + 16 * part;
#pragma unroll
            for (int x4 = 0; x4 < 2; ++x4) { const v4f w0 = *(const LAS v4f*)(wp + 4 * x4), w1 = *(const LAS v4f*)(wp + 8 + 4 * x4);
                a[4 * x4] += w0.x * x0[4 * x4]; a[4 * x4 + 1] += w0.y * x0[4 * x4 + 1]; a[4 * x4 + 2] += w0.z * x0[4 * x4 + 2]; a[4 * x4 + 3] += w0.w * x0[4 * x4 + 3];
                a[8 + 4 * x4] += w1.x * x1[4 * x4]; a[8 + 4 * x4 + 1] += w1.y * x1[4 * x4 + 1]; a[8 + 4 * x4 + 2] += w1.z * x1[4 * x4 + 2]; a[8 + 4 * x4 + 3] += w1.w * x1[4 * x4 + 3]; } }
        float ss = 0.f;
#pragma unroll
        for (int x = 0; x < 16; ++x) { a[x] = siluf_(a[x]); ss += a[x] * a[x]; }
        if (i < 2) { ss = sum8(ss); const float r = rsqrtf(ss + 1e-6f) * (i == 0 ? 0.08838834764831845f : 1.f);
#pragma unroll
            for (int x = 0; x < 16; ++x) a[x] *= r;
            LAS float* dst = (i == 0 ? qs : ks) + tk * QP + 16 * part;
#pragma unroll
            for (int x4 = 0; x4 < 4; ++x4) *(LAS v4f*)(dst + 4 * x4) = (v4f){a[4 * x4], a[4 * x4 + 1], a[4 * x4 + 2], a[4 * x4 + 3]}; }
        else {
#pragma unroll
            for (int x = 0; x < 16; ++x) av[x] = a[x]; } }
      __syncthreads();
      { LAS float* dst = vs + tk * QP + 16 * part;
#pragma unroll
        for (int x4 = 0; x4 < 4; ++x4) *(LAS v4f*)(dst + 4 * x4) = (v4f){av[4 * x4], av[4 * x4 + 1], av[4 * x4 + 2], av[4 * x4 + 3]}; } }
    if (wave == 0) { const float bb = gate_b, aa = gate_a;
        const float g = -__expf(p.in[I_ALOG][l * 4 + h]) * softplusf_(aa + p.in[I_DTB][l * 4 + h]);
        const float gc = wave_scan_incl(g), bt = sigmoidf_(bb); gcs[lane] = gc; bts[lane] = bt; btg[lane] = bt * __expf(gc); }
    __syncthreads();
    { const int ti = wave >> 1, c16 = lane & 15, g4 = lane >> 4, i = 16 * ti + c16; const float gi = gcs[i], bi = bts[i];
#define GDN_F8(dst, base) do { const v4f _a = *(const LAS v4f*)(base), _b = *(const LAS v4f*)((base) + 4); const v4u _w = (v4u){pg8::cvt_pk_bf16(_a.x, _a.y), pg8::cvt_pk_bf16(_a.z, _a.w), pg8::cvt_pk_bf16(_b.x, _b.y), pg8::cvt_pk_bf16(_b.z, _b.w)}; dst = __builtin_bit_cast(bf16x8_t, _w); } while (0)
      bf16x8_t bk[4], bq[4];
#pragma unroll
      for (int s4 = 0; s4 < 4; ++s4) { GDN_F8(bk[s4], ks + i * QP + 32 * s4 + 8 * g4); GDN_F8(bq[s4], qs + i * QP + 32 * s4 + 8 * g4); }
#pragma unroll
      for (int jj = 0; jj < 2; ++jj) { const int tj = 2 * (wave & 1) + jj; v4f lv = (v4f){0.f, 0.f, 0.f, 0.f}; v2u aw = (v2u){0u, 0u};
          if (tj <= ti) { pg8::f32x4 dk = {0.f, 0.f, 0.f, 0.f}, dq = {0.f, 0.f, 0.f, 0.f};
#pragma unroll
              for (int s4 = 0; s4 < 4; ++s4) { bf16x8_t a; GDN_F8(a, ks + (16 * tj + c16) * QP + 32 * s4 + 8 * g4);
                  dk = __builtin_amdgcn_mfma_f32_16x16x32_bf16(a, bk[s4], dk, 0, 0, 0); dq = __builtin_amdgcn_mfma_f32_16x16x32_bf16(a, bq[s4], dq, 0, 0, 0); }
              float l4[4], a4[4];
#pragma unroll
              for (int r = 0; r < 4; ++r) { const int j = 16 * tj + 4 * g4 + r; const float dc = __expf(gi - gcs[j]); l4[r] = (j < i) ? bi * dk[r] * dc : 0.f; a4[r] = (j <= i) ? dq[r] * dc : 0.f; }
              lv = (v4f){l4[0], l4[1], l4[2], l4[3]}; aw = (v2u){pk2(a4[0], a4[1]), pk2(a4[2], a4[3])}; }
          *(LAS v4f*)(Ls + i * 68 + 16 * tj + 4 * g4) = lv; *(v2u*)(GAT + i * 64 + 16 * tj + 4 * g4) = aw; }
#undef GDN_F8
    }
    __syncthreads();
    if (tid < 256) {
        const int c = tid; int vz; asm volatile("v_mov_b32 %0, 0" : "=v"(vz));
        const LAS float* rp = (c < 128) ? (vs + c) : (ks + (c - 128)); const LAS float* mp = ((c < 128) ? bts : btg) + vz;
#define GDN_RHS(i) (rp[(i) * QP] * mp[(i)])
#define GDN_L4(i, j4) (*(const LAS v4f*)(Ls + (i) * 68 + 4 * (j4) + vz))
        float x0 = GDN_RHS(0); __builtin_amdgcn_sched_barrier(0);
        float x1 = GDN_RHS(1); { const v4f l0 = GDN_L4(1, 0); __builtin_amdgcn_sched_barrier(0); x1 -= l0.x * x0; } __builtin_amdgcn_sched_barrier(0);
        float x2 = GDN_RHS(2); { const v4f l0 = GDN_L4(2, 0); __builtin_amdgcn_sched_barrier(0); x2 -= l0.x * x0; x2 -= l0.y * x1; } __builtin_amdgcn_sched_barrier(0);
        float x3 = GDN_RHS(3); { const v4f l0 = GDN_L4(3, 0); __builtin_amdgcn_sched_barrier(0); x3 -= l0.x * x0; x3 -= l0.y * x1; x3 -= l0.z * x2; } __builtin_amdgcn_sched_barrier(0);
        float x4 = GDN_RHS(4); { const v4f l0 = GDN_L4(4, 0); __builtin_amdgcn_sched_barrier(0); x4 -= l0.x * x0; x4 -= l0.y * x1; x4 -= l0.z * x2; x4 -= l0.w * x3; } __builtin_amdgcn_sched_barrier(0);
        float x5 = GDN_RHS(5); { const v4f l0 = GDN_L4(5, 0); const v4f l1 = GDN_L4(5, 1); __builtin_amdgcn_sched_barrier(0); x5 -= l0.x * x0; x5 -= l0.y * x1; x5 -= l0.z * x2; x5 -= l0.w * x3; x5 -= l1.x * x4; } __builtin_amdgcn_sched_barrier(0);
        float x6 = GDN_RHS(6); { const v4f l0 = GDN_L4(6, 0); const v4f l1 = GDN_L4(6, 1); __builtin_amdgcn_sched_barrier(0); x6 -= l0.x * x0; x6 -= l0.y * x1; x6 -= l0.z * x2; x6 -= l0.w * x3; x6 -= l1.x * x4; x6 -= l1.y * x5; } __builtin_amdgcn_sched_barrier(0);
        float x7 = GDN_RHS(7); { const v4f l0 = GDN_L4(7, 0); const v4f l1 = GDN_L4(7, 1); __builtin_amdgcn_sched_barrier(0); x7 -= l0.x * x0; x7 -= l0.y * x1; x7 -= l0.z * x2; x7 -= l0.w * x3; x7 -= l1.x * x4; x7 -= l1.y * x5; x7 -= l1.z * x6; } __builtin_amdgcn_sched_barrier(0);
        float x8 = GDN_RHS(8); { const v4f l0 = GDN_L4(8, 0); const v4f l1 = GDN_L4(8, 1); __builtin_amdgcn_sched_barrier(0); x8 -= l0.x * x0; x8 -= l0.y * x1; x8 -= l0.z * x2; x8 -= l0.w * x3; x8 -= l1.x * x4; x8 -= l1.y * x5; x8 -= l1.z * x6; x8 -= l1.w * x7; } __builtin_amdgcn_sched_barrier(0);
        float x9 = GDN_RHS(9); { const v4f l0 = GDN_L4(9, 0); const v4f l1 = GDN_L4(9, 1); const v4f l2 = GDN_L4(9, 2); __builtin_amdgcn_sched_barrier(0); x9 -= l0.x * x0; x9 -= l0.y * x1; x9 -= l0.z * x2; x9 -= l0.w * x3; x9 -= l1.x * x4; x9 -= l1.y * x5; x9 -= l1.z * x6; x9 -= l1.w * x7; x9 -= l2.x * x8; } __builtin_amdgcn_sched_barrier(0);
        float x10 = GDN_RHS(10); { const v4f l0 = GDN_L4(10, 0); const v4f l1 = GDN_L4(10, 1); const v4f l2 = GDN_L4(10, 2); __builtin_amdgcn_sched_barrier(0); x10 -= l0.x * x0; x10 -= l0.y * x1; x10 -= l0.z * x2; x10 -= l0.w * x3; x10 -= l1.x * x4; x10 -= l1.y * x5; x10 -= l1.z * x6; x10 -= l1.w * x7; x10 -= l2.x * x8; x10 -= l2.y * x9; } __builtin_amdgcn_sched_barrier(0);
        float x11 = GDN_RHS(11); { const v4f l0 = GDN_L4(11, 0); const v4f l1 = GDN_L4(11, 1); const v4f l2 = GDN_L4(11, 2); __builtin_amdgcn_sched_barrier(0); x11 -= l0.x * x0; x11 -= l0.y * x1; x11 -= l0.z * x2; x11 -= l0.w * x3; x11 -= l1.x * x4; x11 -= l1.y * x5; x11 -= l1.z * x6; x11 -= l1.w * x7; x11 -= l2.x * x8; x11 -= l2.y * x9; x11 -= l2.z * x10; } __builtin_amdgcn_sched_barrier(0);
        float x12 = GDN_RHS(12); { const v4f l0 = GDN_L4(12, 0); const v4f l1 = GDN_L4(12, 1); const v4f l2 = GDN_L4(12, 2); __builtin_amdgcn_sched_barrier(0); x12 -= l0.x * x0; x12 -= l0.y * x1; x12 -= l0.z * x2; x12 -= l0.w * x3; x12 -= l1.x * x4; x12 -= l1.y * x5; x12 -= l1.z * x6; x12 -= l1.w * x7; x12 -= l2.x * x8; x12 -= l2.y * x9; x12 -= l2.z * x10; x12 -= l2.w * x11; } __builtin_amdgcn_sched_barrier(0);
        float x13 = GDN_RHS(13); { const v4f l0 = GDN_L4(13, 0); const v4f l1 = GDN_L4(13, 1); const v4f l2 = GDN_L4(13, 2); const v4f l3 = GDN_L4(13, 3); __builtin_amdgcn_sched_barrier(0); x13 -= l0.x * x0; x13 -= l0.y * x1; x13 -= l0.z * x2; x13 -= l0.w * x3; x13 -= l1.x * x4; x13 -= l1.y * x5; x13 -= l1.z * x6; x13 -= l1.w * x7; x13 -= l2.x * x8; x13 -= l2.y * x9; x13 -= l2.z * x10; x13 -= l2.w * x11; x13 -= l3.x * x12; } __builtin_amdgcn_sched_barrier(0);
        float x14 = GDN_RHS(14); { const v4f l0 = GDN_L4(14, 0); const v4f l1 = GDN_L4(14, 1); const v4f l2 = GDN_L4(14, 2); const v4f l3 = GDN_L4(14, 3); __builtin_amdgcn_sched_barrier(0); x14 -= l0.x * x0; x14 -= l0.y * x1; x14 -= l0.z * x2; x14 -= l0.w * x3; x14 -= l1.x * x4; x14 -= l1.y * x5; x14 -= l1.z * x6; x14 -= l1.w * x7; x14 -= l2.x * x8; x14 -= l2.y * x9; x14 -= l2.z * x10; x14 -= l2.w * x11; x14 -= l3.x * x12; x14 -= l3.y * x13; } __builtin_amdgcn_sched_barrier(0);
        float x15 = GDN_RHS(15); { const v4f l0 = GDN_L4(15, 0); const v4f l1 = GDN_L4(15, 1); const v4f l2 = GDN_L4(15, 2); const v4f l3 = GDN_L4(15, 3); __builtin_amdgcn_sched_barrier(0); x15 -= l0.x * x0; x15 -= l0.y * x1; x15 -= l0.z * x2; x15 -= l0.w * x3; x15 -= l1.x * x4; x15 -= l1.y * x5; x15 -= l1.z * x6; x15 -= l1.w * x7; x15 -= l2.x * x8; x15 -= l2.y * x9; x15 -= l2.z * x10; x15 -= l2.w * x11; x15 -= l3.x * x12; x15 -= l3.y * x13; x15 -= l3.z * x14; } __builtin_amdgcn_sched_barrier(0);
        float x16 = GDN_RHS(16); { const v4f l0 = GDN_L4(16, 0); const v4f l1 = GDN_L4(16, 1); const v4f l2 = GDN_L4(16, 2); const v4f l3 = GDN_L4(16, 3); __builtin_amdgcn_sched_barrier(0); x16 -= l0.x * x0; x16 -= l0.y * x1; x16 -= l0.z * x2; x16 -= l0.w * x3; x16 -= l1.x * x4; x16 -= l1.y * x5; x16 -= l1.z * x6; x16 -= l1.w * x7; x16 -= l2.x * x8; x16 -= l2.y * x9; x16 -= l2.z * x10; x16 -= l2.w * x11; x16 -= l3.x * x12; x16 -= l3.y * x13; x16 -= l3.z * x14; x16 -= l3.w * x15; } __builtin_amdgcn_sched_barrier(0);
        float x17 = GDN_RHS(17); { const v4f l0 = GDN_L4(17, 0); const v4f l1 = GDN_L4(17, 1); const v4f l2 = GDN_L4(17, 2); const v4f l3 = GDN_L4(17, 3); const v4f l4 = GDN_L4(17, 4); __builtin_amdgcn_sched_barrier(0); x17 -= l0.x * x0; x17 -= l0.y * x1; x17 -= l0.z * x2; x17 -= l0.w * x3; x17 -= l1.x * x4; x17 -= l1.y * x5; x17 -= l1.z * x6; x17 -= l1.w * x7; x17 -= l2.x * x8; x17 -= l2.y * x9; x17 -= l2.z * x10; x17 -= l2.w * x11; x17 -= l3.x * x12; x17 -= l3.y * x13; x17 -= l3.z * x14; x17 -= l3.w * x15; x17 -= l4.x * x16; } __builtin_amdgcn_sched_barrier(0);
        float x18 = GDN_RHS(18); { const v4f l0 = GDN_L4(18, 0); const v4f l1 = GDN_L4(18, 1); const v4f l2 = GDN_L4(18, 2); const v4f l3 = GDN_L4(18, 3); const v4f l4 = GDN_L4(18, 4); __builtin_amdgcn_sched_barrier(0); x18 -= l0.x * x0; x18 -= l0.y * x1; x18 -= l0.z * x2; x18 -= l0.w * x3; x18 -= l1.x * x4; x18 -= l1.y * x5; x18 -= l1.z * x6; x18 -= l1.w * x7; x18 -= l2.x * x8; x18 -= l2.y * x9; x18 -= l2.z * x10; x18 -= l2.w * x11; x18 -= l3.x * x12; x18 -= l3.y * x13; x18 -= l3.z * x14; x18 -= l3.w * x15; x18 -= l4.x * x16; x18 -= l4.y * x17; } __builtin_amdgcn_sched_barrier(0);
        float x19 = GDN_RHS(19); { const v4f l0 = GDN_L4(19, 0); const v4f l1 = GDN_L4(19, 1); const v4f l2 = GDN_L4(19, 2); const v4f l3 = GDN_L4(19, 3); const v4f l4 = GDN_L4(19, 4); __builtin_amdgcn_sched_barrier(0); x19 -= l0.x * x0; x19 -= l0.y * x1; x19 -= l0.z * x2; x19 -= l0.w * x3; x19 -= l1.x * x4; x19 -= l1.y * x5; x19 -= l1.z * x6; x19 -= l1.w * x7; x19 -= l2.x * x8; x19 -= l2.y * x9; x19 -= l2.z * x10; x19 -= l2.w * x11; x19 -= l3.x * x12; x19 -= l3.y * x13; x19 -= l3.z * x14; x19 -= l3.w * x15; x19 -= l4.x * x16; x19 -= l4.y * x17; x19 -= l4.z * x18; } __builtin_amdgcn_sched_barrier(0);
        float x20 = GDN_RHS(20); { const v4f l0 = GDN_L4(20, 0); const v4f l1 = GDN_L4(20, 1); const v4f l2 = GDN_L4(20, 2); const v4f l3 = GDN_L4(20, 3); const v4f l4 = GDN_L4(20, 4); __builtin_amdgcn_sched_barrier(0); x20 -= l0.x * x0; x20 -= l0.y * x1; x20 -= l0.z * x2; x20 -= l0.w * x3; x20 -= l1.x * x4; x20 -= l1.y * x5; x20 -= l1.z * x6; x20 -= l1.w * x7; x20 -= l2.x * x8; x20 -= l2.y * x9; x20 -= l2.z * x10; x20 -= l2.w * x11; x20 -= l3.x * x12; x20 -= l3.y * x13; x20 -= l3.z * x14; x20 -= l3.w * x15; x20 -= l4.x * x16; x20 -= l4.y * x17; x20 -= l4.z * x18; x20 -= l4.w * x19; } __builtin_amdgcn_sched_barrier(0);
        float x21 = GDN_RHS(21); { const v4f l0 = GDN_L4(21, 0); const v4f l1 = GDN_L4(21, 1); const v4f l2 = GDN_L4(21, 2); const v4f l3 = GDN_L4(21, 3); const v4f l4 = GDN_L4(21, 4); const v4f l5 = GDN_L4(21, 5); __builtin_amdgcn_sched_barrier(0); x21 -= l0.x * x0; x21 -= l0.y * x1; x21 -= l0.z * x2; x21 -= l0.w * x3; x21 -= l1.x * x4; x21 -= l1.y * x5; x21 -= l1.z * x6; x21 -= l1.w * x7; x21 -= l2.x * x8; x21 -= l2.y * x9; x21 -= l2.z * x10; x21 -= l2.w * x11; x21 -= l3.x * x12; x21 -= l3.y * x13; x21 -= l3.z * x14; x21 -= l3.w * x15; x21 -= l4.x * x16; x21 -= l4.y * x17; x21 -= l4.z * x18; x21 -= l4.w * x19; x21 -= l5.x * x20; } __builtin_amdgcn_sched_barrier(0);
        float x22 = GDN_RHS(22); { const v4f l0 = GDN_L4(22, 0); const v4f l1 = GDN_L4(22, 1); const v4f l2 = GDN_L4(22, 2); const v4f l3 = GDN_L4(22, 3); const v4f l4 = GDN_L4(22, 4); const v4f l5 = GDN_L4(22, 5); __builtin_amdgcn_sched_barrier(0); x22 -= l0.x * x0; x22 -= l0.y * x1; x22 -= l0.z * x2; x22 -= l0.w * x3; x22 -= l1.x * x4; x22 -= l1.y * x5; x22 -= l1.z * x6; x22 -= l1.w * x7; x22 -= l2.x * x8; x22 -= l2.y * x9; x22 -= l2.z * x10; x22 -= l2.w * x11; x22 -= l3.x * x12; x22 -= l3.y * x13; x22 -= l3.z * x14; x22 -= l3.w * x15; x22 -= l4.x * x16; x22 -= l4.y * x17; x22 -= l4.z * x18; x22 -= l4.w * x19; x22 -= l5.x * x20; x22 -= l5.y * x21; } __builtin_amdgcn_sched_barrier(0);
        float x23 = GDN_RHS(23); { const v4f l0 = GDN_L4(23, 0); const v4f l1 = GDN_L4(23, 1); const v4f l2 = GDN_L4(23, 2); const v4f l3 = GDN_L4(23, 3); const v4f l4 = GDN_L4(23, 4); const v4f l5 = GDN_L4(23, 5); __builtin_amdgcn_sched_barrier(0); x23 -= l0.x * x0; x23 -= l0.y * x1; x23 -= l0.z * x2; x23 -= l0.w * x3; x23 -= l1.x * x4; x23 -= l1.y * x5; x23 -= l1.z * x6; x23 -= l1.w * x7; x23 -= l2.x * x8; x23 -= l2.y * x9; x23 -= l2.z * x10; x23 -= l2.w * x11; x23 -= l3.x * x12; x23 -= l3.y * x13; x23 -= l3.z * x14; x23 -= l3.w * x15; x23 -= l4.x * x16; x23 -= l4.y * x17; x23 -= l4.z * x18; x23 -= l4.w * x19; x23 -= l5.x * x20; x23 -= l5.y * x21; x23 -= l5.z * x22; } __builtin_amdgcn_sched_barrier(0);
        float x24 = GDN_RHS(24); { const v4f l0 = GDN_L4(24, 0); const v4f l1 = GDN_L4(24, 1); const v4f l2 = GDN_L4(24, 2); const v4f l3 = GDN_L4(24, 3); const v4f l4 = GDN_L4(24, 4); const v4f l5 = GDN_L4(24, 5); __builtin_amdgcn_sched_barrier(0); x24 -= l0.x * x0; x24 -= l0.y * x1; x24 -= l0.z * x2; x24 -= l0.w * x3; x24 -= l1.x * x4; x24 -= l1.y * x5; x24 -= l1.z * x6; x24 -= l1.w * x7; x24 -= l2.x * x8; x24 -= l2.y * x9; x24 -= l2.z * x10; x24 -= l2.w * x11; x24 -= l3.x * x12; x24 -= l3.y * x13; x24 -= l3.z * x14; x24 -= l3.w * x15; x24 -= l4.x * x16; x24 -= l4.y * x17; x24 -= l4.z * x18; x24 -= l4.w * x19; x24 -= l5.x * x20; x24 -= l5.y * x21; x24 -= l5.z * x22; x24 -= l5.w * x23; } __builtin_amdgcn_sched_barrier(0);
        float x25 = GDN_RHS(25); { const v4f l0 = GDN_L4(25, 0); const v4f l1 = GDN_L4(25, 1); const v4f l2 = GDN_L4(25, 2); const v4f l3 = GDN_L4(25, 3); const v4f l4 = GDN_L4(25, 4); const v4f l5 = GDN_L4(25, 5); const v4f l6 = GDN_L4(25, 6); __builtin_amdgcn_sched_barrier(0); x25 -= l0.x * x0; x25 -= l0.y * x1; x25 -= l0.z * x2; x25 -= l0.w * x3; x25 -= l1.x * x4; x25 -= l1.y * x5; x25 -= l1.z * x6; x25 -= l1.w * x7; x25 -= l2.x * x8; x25 -= l2.y * x9; x25 -= l2.z * x10; x25 -= l2.w * x11; x25 -= l3.x * x12; x25 -= l3.y * x13; x25 -= l3.z * x14; x25 -= l3.w * x15; x25 -= l4.x * x16; x25 -= l4.y * x17; x25 -= l4.z * x18; x25 -= l4.w * x19; x25 -= l5.x * x20; x25 -= l5.y * x21; x25 -= l5.z * x22; x25 -= l5.w * x23; x25 -= l6.x * x24; } __builtin_amdgcn_sched_barrier(0);
        float x26 = GDN_RHS(26); { const v4f l0 = GDN_L4(26, 0); const v4f l1 = GDN_L4(26, 1); const v4f l2 = GDN_L4(26, 2); const v4f l3 = GDN_L4(26, 3); const v4f l4 = GDN_L4(26, 4); const v4f l5 = GDN_L4(26, 5); const v4f l6 = GDN_L4(26, 6); __builtin_amdgcn_sched_barrier(0); x26 -= l0.x * x0; x26 -= l0.y * x1; x26 -= l0.z * x2; x26 -= l0.w * x3; x26 -= l1.x * x4; x26 -= l1.y * x5; x26 -= l1.z * x6; x26 -= l1.w * x7; x26 -= l2.x * x8; x26 -= l2.y * x9; x26 -= l2.z * x10; x26 -= l2.w * x11; x26 -= l3.x * x12; x26 -= l3.y * x13; x26 -= l3.z * x14; x26 -= l3.w * x15; x26 -= l4.x * x16; x26 -= l4.y * x17; x26 -= l4.z * x18; x26 -= l4.w * x19; x26 -= l5.x * x20; x26 -= l5.y * x21; x26 -= l5.z * x22; x26 -= l5.w * x23; x26 -= l6.x * x24; x26 -= l6.y * x25; } __builtin_amdgcn_sched_barrier(0);
        float x27 = GDN_RHS(27); { const v4f l0 = GDN_L4(27, 0); const v4f l1 = GDN_L4(27, 1); const v4f l2 = GDN_L4(27, 2); const v4f l3 = GDN_L4(27, 3); const v4f l4 = GDN_L4(27, 4); const v4f l5 = GDN_L4(27, 5); const v4f l6 = GDN_L4(27, 6); __builtin_amdgcn_sched_barrier(0); x27 -= l0.x * x0; x27 -= l0.y * x1; x27 -= l0.z * x2; x27 -= l0.w * x3; x27 -= l1.x * x4; x27 -= l1.y * x5; x27 -= l1.z * x6; x27 -= l1.w * x7; x27 -= l2.x * x8; x27 -= l2.y * x9; x27 -= l2.z * x10; x27 -= l2.w * x11; x27 -= l3.x * x12; x27 -= l3.y * x13; x27 -= l3.z * x14; x27 -= l3.w * x15; x27 -= l4.x * x16; x27 -= l4.y * x17; x27 -= l4.z * x18; x27 -= l4.w * x19; x27 -= l5.x * x20; x27 -= l5.y * x21; x27 -= l5.z * x22; x27 -= l5.w * x23; x27 -= l6.x * x24; x27 -= l6.y * x25; x27 -= l6.z * x26; } __builtin_amdgcn_sched_barrier(0);
        float x28 = GDN_RHS(28); { const v4f l0 = GDN_L4(28, 0); const v4f l1 = GDN_L4(28, 1); const v4f l2 = GDN_L4(28, 2); const v4f l3 = GDN_L4(28, 3); const v4f l4 = GDN_L4(28, 4); const v4f l5 = GDN_L4(28, 5); const v4f l6 = GDN_L4(28, 6); __builtin_amdgcn_sched_barrier(0); x28 -= l0.x * x0; x28 -= l0.y * x1; x28 -= l0.z * x2; x28 -= l0.w * x3; x28 -= l1.x * x4; x28 -= l1.y * x5; x28 -= l1.z * x6; x28 -= l1.w * x7; x28 -= l2.x * x8; x28 -= l2.y * x9; x28 -= l2.z * x10; x28 -= l2.w * x11; x28 -= l3.x * x12; x28 -= l3.y * x13; x28 -= l3.z * x14; x28 -= l3.w * x15; x28 -= l4.x * x16; x28 -= l4.y * x17; x28 -= l4.z * x18; x28 -= l4.w * x19; x28 -= l5.x * x20; x28 -= l5.y * x21; x28 -= l5.z * x22; x28 -= l5.w * x23; x28 -= l6.x * x24; x28 -= l6.y * x25; x28 -= l6.z * x26; x28 -= l6.w * x27; } __builtin_amdgcn_sched_barrier(0);
        float x29 = GDN_RHS(29); { const v4f l0 = GDN_L4(29, 0); const v4f l1 = GDN_L4(29, 1); const v4f l2 = GDN_L4(29, 2); const v4f l3 = GDN_L4(29, 3); const v4f l4 = GDN_L4(29, 4); const v4f l5 = GDN_L4(29, 5); const v4f l6 = GDN_L4(29, 6); const v4f l7 = GDN_L4(29, 7); __builtin_amdgcn_sched_barrier(0); x29 -= l0.x * x0; x29 -= l0.y * x1; x29 -= l0.z * x2; x29 -= l0.w * x3; x29 -= l1.x * x4; x29 -= l1.y * x5; x29 -= l1.z * x6; x29 -= l1.w * x7; x29 -= l2.x * x8; x29 -= l2.y * x9; x29 -= l2.z * x10; x29 -= l2.w * x11; x29 -= l3.x * x12; x29 -= l3.y * x13; x29 -= l3.z * x14; x29 -= l3.w * x15; x29 -= l4.x * x16; x29 -= l4.y * x17; x29 -= l4.z * x18; x29 -= l4.w * x19; x29 -= l5.x * x20; x29 -= l5.y * x21; x29 -= l5.z * x22; x29 -= l5.w * x23; x29 -= l6.x * x24; x29 -= l6.y * x25; x29 -= l6.z * x26; x29 -= l6.w * x27; x29 -= l7.x * x28; } __builtin_amdgcn_sched_barrier(0);
        float x30 = GDN_RHS(30); { const v4f l0 = GDN_L4(30, 0); const v4f l1 = GDN_L4(30, 1); const v4f l2 = GDN_L4(30, 2); const v4f l3 = GDN_L4(30, 3); const v4f l4 = GDN_L4(30, 4); const v4f l5 = GDN_L4(30, 5); const v4f l6 = GDN_L4(30, 6); const v4f l7 = GDN_L4(30, 7); __builtin_amdgcn_sched_barrier(0); x30 -= l0.x * x0; x30 -= l0.y * x1; x30 -= l0.z * x2; x30 -= l0.w * x3; x30 -= l1.x * x4; x30 -= l1.y * x5; x30 -= l1.z * x6; x30 -= l1.w * x7; x30 -= l2.x * x8; x30 -= l2.y * x9; x30 -= l2.z * x10; x30 -= l2.w * x11; x30 -= l3.x * x12; x30 -= l3.y * x13; x30 -= l3.z * x14; x30 -= l3.w * x15; x30 -= l4.x * x16; x30 -= l4.y * x17; x30 -= l4.z * x18; x30 -= l4.w * x19; x30 -= l5.x * x20; x30 -= l5.y * x21; x30 -= l5.z * x22; x30 -= l5.w * x23; x30 -= l6.x * x24; x30 -= l6.y * x25; x30 -= l6.z * x26; x30 -= l6.w * x27; x30 -= l7.x * x28; x30 -= l7.y * x29; } __builtin_amdgcn_sched_barrier(0);
        float x31 = GDN_RHS(31); { const v4f l0 = GDN_L4(31, 0); const v4f l1 = GDN_L4(31, 1); const v4f l2 = GDN_L4(31, 2); const v4f l3 = GDN_L4(31, 3); const v4f l4 = GDN_L4(31, 4); const v4f l5 = GDN_L4(31, 5); const v4f l6 = GDN_L4(31, 6); const v4f l7 = GDN_L4(31, 7); __builtin_amdgcn_sched_barrier(0); x31 -= l0.x * x0; x31 -= l0.y * x1; x31 -= l0.z * x2; x31 -= l0.w * x3; x31 -= l1.x * x4; x31 -= l1.y * x5; x31 -= l1.z * x6; x31 -= l1.w * x7; x31 -= l2.x * x8; x31 -= l2.y * x9; x31 -= l2.z * x10; x31 -= l2.w * x11; x31 -= l3.x * x12; x31 -= l3.y * x13; x31 -= l3.z * x14; x31 -= l3.w * x15; x31 -= l4.x * x16; x31 -= l4.y * x17; x31 -= l4.z * x18; x31 -= l4.w * x19; x31 -= l5.x * x20; x31 -= l5.y * x21; x31 -= l5.z * x22; x31 -= l5.w * x23; x31 -= l6.x * x24; x31 -= l6.y * x25; x31 -= l6.z * x26; x31 -= l6.w * x27; x31 -= l7.x * x28; x31 -= l7.y * x29; x31 -= l7.z * x30; } __builtin_amdgcn_sched_barrier(0);
        float x32 = GDN_RHS(32); { const v4f l0 = GDN_L4(32, 0); const v4f l1 = GDN_L4(32, 1); const v4f l2 = GDN_L4(32, 2); const v4f l3 = GDN_L4(32, 3); const v4f l4 = GDN_L4(32, 4); const v4f l5 = GDN_L4(32, 5); const v4f l6 = GDN_L4(32, 6); const v4f l7 = GDN_L4(32, 7); __builtin_amdgcn_sched_barrier(0); x32 -= l0.x * x0; x32 -= l0.y * x1; x32 -= l0.z * x2; x32 -= l0.w * x3; x32 -= l1.x * x4; x32 -= l1.y * x5; x32 -= l1.z * x6; x32 -= l1.w * x7; x32 -= l2.x * x8; x32 -= l2.y * x9; x32 -= l2.z * x10; x32 -= l2.w * x11; x32 -= l3.x * x12; x32 -= l3.y * x13; x32 -= l3.z * x14; x32 -= l3.w * x15; x32 -= l4.x * x16; x32 -= l4.y * x17; x32 -= l4.z * x18; x32 -= l4.w * x19; x32 -= l5.x * x20; x32 -= l5.y * x21; x32 -= l5.z * x22; x32 -= l5.w * x23; x32 -= l6.x * x24; x32 -= l6.y * x25; x32 -= l6.z * x26; x32 -= l6.w * x27; x32 -= l7.x * x28; x32 -= l7.y * x29; x32 -= l7.z * x30; x32 -= l7.w * x31; } __builtin_amdgcn_sched_barrier(0);
        float x33 = GDN_RHS(33); { const v4f l0 = GDN_L4(33, 0); const v4f l1 = GDN_L4(33, 1); const v4f l2 = GDN_L4(33, 2); const v4f l3 = GDN_L4(33, 3); const v4f l4 = GDN_L4(33, 4); const v4f l5 = GDN_L4(33, 5); const v4f l6 = GDN_L4(33, 6); const v4f l7 = GDN_L4(33, 7); __builtin_amdgcn_sched_barrier(0); x33 -= l0.x * x0; x33 -= l0.y * x1; x33 -= l0.z * x2; x33 -= l0.w * x3; x33 -= l1.x * x4; x33 -= l1.y * x5; x33 -= l1.z * x6; x33 -= l1.w * x7; x33 -= l2.x * x8; x33 -= l2.y * x9; x33 -= l2.z * x10; x33 -= l2.w * x11; x33 -= l3.x * x12; x33 -= l3.y * x13; x33 -= l3.z * x14; x33 -= l3.w * x15; x33 -= l4.x * x16; x33 -= l4.y * x17; x33 -= l4.z * x18; x33 -= l4.w * x19; x33 -= l5.x * x20; x33 -= l5.y * x21; x33 -= l5.z * x22; x33 -= l5.w * x23; x33 -= l6.x * x24; x33 -= l6.y * x25; x33 -= l6.z * x26; x33 -= l6.w * x27; x33 -= l7.x * x28; x33 -= l7.y * x29; x33 -= l7.z * x30; x33 -= l7.w * x31; } __builtin_amdgcn_sched_barrier(0); { const v4f l8 = GDN_L4(33, 8); __builtin_amdgcn_sched_barrier(0); x33 -= l8.x * x32; } __builtin_amdgcn_sched_barrier(0);
        float x34 = GDN_RHS(34); { const v4f l0 = GDN_L4(34, 0); const v4f l1 = GDN_L4(34, 1); const v4f l2 = GDN_L4(34, 2); const v4f l3 = GDN_L4(34, 3); const v4f l4 = GDN_L4(34, 4); const v4f l5 = GDN_L4(34, 5); const v4f l6 = GDN_L4(34, 6); const v4f l7 = GDN_L4(34, 7); __builtin_amdgcn_sched_barrier(0); x34 -= l0.x * x0; x34 -= l0.y * x1; x34 -= l0.z * x2; x34 -= l0.w * x3; x34 -= l1.x * x4; x34 -= l1.y * x5; x34 -= l1.z * x6; x34 -= l1.w * x7; x34 -= l2.x * x8; x34 -= l2.y * x9; x34 -= l2.z * x10; x34 -= l2.w * x11; x34 -= l3.x * x12; x34 -= l3.y * x13; x34 -= l3.z * x14; x34 -= l3.w * x15; x34 -= l4.x * x16; x34 -= l4.y * x17; x34 -= l4.z * x18; x34 -= l4.w * x19; x34 -= l5.x * x20; x34 -= l5.y * x21; x34 -= l5.z * x22; x34 -= l5.w * x23; x34 -= l6.x * x24; x34 -= l6.y * x25; x34 -= l6.z * x26; x34 -= l6.w * x27; x34 -= l7.x * x28; x34 -= l7.y * x29; x34 -= l7.z * x30; x34 -= l7.w * x31; } __builtin_amdgcn_sched_barrier(0); { const v4f l8 = GDN_L4(34, 8); __builtin_amdgcn_sched_barrier(0); x34 -= l8.x * x32; x34 -= l8.y * x33; } __builtin_amdgcn_sched_barrier(0);
        float x35 = GDN_RHS(35); { const v4f l0 = GDN_L4(35, 0); const v4f l1 = GDN_L4(35, 1); const v4f l2 = GDN_L4(35, 2); const v4f l3 = GDN_L4(35, 3); const v4f l4 = GDN_L4(35, 4); const v4f l5 = GDN_L4(35, 5); const v4f l6 = GDN_L4(35, 6); const v4f l7 = GDN_L4(35, 7); __builtin_amdgcn_sched_barrier(0); x35 -= l0.x * x0; x35 -= l0.y * x1; x35 -= l0.z * x2; x35 -= l0.w * x3; x35 -= l1.x * x4; x35 -= l1.y * x5; x35 -= l1.z * x6; x35 -= l1.w * x7; x35 -= l2.x * x8; x35 -= l2.y * x9; x35 -= l2.z * x10; x35 -= l2.w * x11; x35 -= l3.x * x12; x35 -= l3.y * x13; x35 -= l3.z * x14; x35 -= l3.w * x15; x35 -= l4.x * x16; x35 -= l4.y * x17; x35 -= l4.z * x18; x35 -= l4.w * x19; x35 -= l5.x * x20; x35 -= l5.y * x21; x35 -= l5.z * x22; x35 -= l5.w * x23; x35 -= l6.x * x24; x35 -= l6.y * x25; x35 -= l6.z * x26; x35 -= l6.w * x27; x35 -= l7.x * x28; x35 -= l7.y * x29; x35 -= l7.z * x30; x35 -= l7.w * x31; } __builtin_amdgcn_sched_barrier(0); { const v4f l8 = GDN_L4(35, 8); __builtin_amdgcn_sched_barrier(0); x35 -= l8.x * x32; x35 -= l8.y * x33; x35 -= l8.z * x34; } __builtin_amdgcn_sched_barrier(0);
        float x36 = GDN_RHS(36); { const v4f l0 = GDN_L4(36, 0); const v4f l1 = GDN_L4(36, 1); const v4f l2 = GDN_L4(36, 2); const v4f l3 = GDN_L4(36, 3); const v4f l4 = GDN_L4(36, 4); const v4f l5 = GDN_L4(36, 5); const v4f l6 = GDN_L4(36, 6); const v4f l7 = GDN_L4(36, 7); __builtin_amdgcn_sched_barrier(0); x36 -= l0.x * x0; x36 -= l0.y * x1; x36 -= l0.z * x2; x36 -= l0.w * x3; x36 -= l1.x * x4; x36 -= l1.y * x5; x36 -= l1.z * x6; x36 -= l1.w * x7; x36 -= l2.x * x8; x36 -= l2.y * x9; x36 -= l2.z * x10; x36 -= l2.w * x11; x36 -= l3.x * x12; x36 -= l3.y * x13; x36 -= l3.z * x14; x36 -= l3.w * x15; x36 -= l4.x * x16; x36 -= l4.y * x17; x36 -= l4.z * x18; x36 -= l4.w * x19; x36 -= l5.x * x20; x36 -= l5.y * x21; x36 -= l5.z * x22; x36 -= l5.w * x23; x36 -= l6.x * x24; x36 -= l6.y * x25; x36 -= l6.z * x26; x36 -= l6.w * x27; x36 -= l7.x * x28; x36 -= l7.y * x29; x36 -= l7.z * x30; x36 -= l7.w * x31; } __builtin_amdgcn_sched_barrier(0); { const v4f l8 = GDN_L4(36, 8); __builtin_amdgcn_sched_barrier(0); x36 -= l8.x * x32; x36 -= l8.y * x33; x36 -= l8.z * x34; x36 -= l8.w * x35; } __builtin_amdgcn_sched_barrier(0);
        float x37 = GDN_RHS(37); { const v4f l0 = GDN_L4(37, 0); const v4f l1 = GDN_L4(37, 1); const v4f l2 = GDN_L4(37, 2); const v4f l3 = GDN_L4(37, 3); const v4f l4 = GDN_L4(37, 4); const v4f l5 = GDN_L4(37, 5); const v4f l6 = GDN_L4(37, 6); const v4f l7 = GDN_L4(37, 7); __builtin_amdgcn_sched_barrier(0); x37 -= l0.x * x0; x37 -= l0.y * x1; x37 -= l0.z * x2; x37 -= l0.w * x3; x37 -= l1.x * x4; x37 -= l1.y * x5; x37 -= l1.z * x6; x37 -= l1.w * x7; x37 -= l2.x * x8; x37 -= l2.y * x9; x37 -= l2.z * x10; x37 -= l2.w * x11; x37 -= l3.x * x12; x37 -= l3.y * x13; x37 -= l3.z * x14; x37 -= l3.w * x15; x37 -= l4.x * x16; x37 -= l4.y * x17; x37 -= l4.z * x18; x37 -= l4.w * x19; x37 -= l5.x * x20; x37 -= l5.y * x21; x37 -= l5.z * x22; x37 -= l5.w * x23; x37 -= l6.x * x24; x37 -= l6.y * x25; x37 -= l6.z * x26; x37 -= l6.w * x27; x37 -= l7.x * x28; x37 -= l7.y * x29; x37 -= l7.z * x30; x37 -= l7.w * x31; } __builtin_amdgcn_sched_barrier(0); { const v4f l8 = GDN_L4(37, 8); const v4f l9 = GDN_L4(37, 9); __builtin_amdgcn_sched_barrier(0); x37 -= l8.x * x32; x37 -= l8.y * x33; x37 -= l8.z * x34; x37 -= l8.w * x35; x37 -= l9.x * x36; } __builtin_amdgcn_sched_barrier(0);
        float x38 = GDN_RHS(38); { const v4f l0 = GDN_L4(38, 0); const v4f l1 = GDN_L4(38, 1); const v4f l2 = GDN_L4(38, 2); const v4f l3 = GDN_L4(38, 3); const v4f l4 = GDN_L4(38, 4); const v4f l5 = GDN_L4(38, 5); const v4f l6 = GDN_L4(38, 6); const v4f l7 = GDN_L4(38, 7); __builtin_amdgcn_sched_barrier(0); x38 -= l0.x * x0; x38 -= l0.y * x1; x38 -= l0.z * x2; x38 -= l0.w * x3; x38 -= l1.x * x4; x38 -= l1.y * x5; x38 -= l1.z * x6; x38 -= l1.w * x7; x38 -= l2.x * x8; x38 -= l2.y * x9; x38 -= l2.z * x10; x38 -= l2.w * x11; x38 -= l3.x * x12; x38 -= l3.y * x13; x38 -= l3.z * x14; x38 -= l3.w * x15; x38 -= l4.x * x16; x38 -= l4.y * x17; x38 -= l4.z * x18; x38 -= l4.w * x19; x38 -= l5.x * x20; x38 -= l5.y * x21; x38 -= l5.z * x22; x38 -= l5.w * x23; x38 -= l6.x * x24; x38 -= l6.y * x25; x38 -= l6.z * x26; x38 -= l6.w * x27; x38 -= l7.x * x28; x38 -= l7.y * x29; x38 -= l7.z * x30; x38 -= l7.w * x31; } __builtin_amdgcn_sched_barrier(0); { const v4f l8 = GDN_L4(38, 8); const v4f l9 = GDN_L4(38, 9); __builtin_amdgcn_sched_barrier(0); x38 -= l8.x * x32; x38 -= l8.y * x33; x38 -= l8.z * x34; x38 -= l8.w * x35; x38 -= l9.x * x36; x38 -= l9.y * x37; } __builtin_amdgcn_sched_barrier(0);
        float x39 = GDN_RHS(39); { const v4f l0 = GDN_L4(39, 0); const v4f l1 = GDN_L4(39, 1); const v4f l2 = GDN_L4(39, 2); const v4f l3 = GDN_L4(39, 3); const v4f l4 = GDN_L4(39, 4); const v4f l5 = GDN_L4(39, 5); const v4f l6 = GDN_L4(39, 6); const v4f l7 = GDN_L4(39, 7); __builtin_amdgcn_sched_barrier(0); x39 -= l0.x * x0; x39 -= l0.y * x1; x39 -= l0.z * x2; x39 -= l0.w * x3; x39 -= l1.x * x4; x39 -= l1.y * x5; x39 -= l1.z * x6; x39 -= l1.w * x7; x39 -= l2.x * x8; x39 -= l2.y * x9; x39 -= l2.z * x10; x39 -= l2.w * x11; x39 -= l3.x * x12; x39 -= l3.y * x13; x39 -= l3.z * x14; x39 -= l3.w * x15; x39 -= l4.x * x16; x39 -= l4.y * x17; x39 -= l4.z * x18; x39 -= l4.w * x19; x39 -= l5.x * x20; x39 -= l5.y * x21; x39 -= l5.z * x22; x39 -= l5.w * x23; x39 -= l6.x * x24; x39 -= l6.y * x25; x39 -= l6.z * x26; x39 -= l6.w * x27; x39 -= l7.x * x28; x39 -= l7.y * x29; x39 -= l7.z * x30; x39 -= l7.w * x31; } __builtin_amdgcn_sched_barrier(0); { const v4f l8 = GDN_L4(39, 8); const v4f l9 = GDN_L4(39, 9); __builtin_amdgcn_sched_barrier(0); x39 -= l8.x * x32; x39 -= l8.y * x33; x39 -= l8.z * x34; x39 -= l8.w * x35; x39 -= l9.x * x36; x39 -= l9.y * x37; x39 -= l9.z * x38; } __builtin_amdgcn_sched_barrier(0);
        float x40 = GDN_RHS(40); { const v4f l0 = GDN_L4(40, 0); const v4f l1 = GDN_L4(40, 1); const v4f l2 = GDN_L4(40, 2); const v4f l3 = GDN_L4(40, 3); const v4f l4 = GDN_L4(40, 4); const v4f l5 = GDN_L4(40, 5); const v4f l6 = GDN_L4(40, 6); const v4f l7 = GDN_L4(40, 7); __builtin_amdgcn_sched_barrier(0); x40 -= l0.x * x0; x40 -= l0.y * x1; x40 -= l0.z * x2; x40 -= l0.w * x3; x40 -= l1.x * x4; x40 -= l1.y * x5; x40 -= l1.z * x6; x40 -= l1.w * x7; x40 -= l2.x * x8; x40 -= l2.y * x9; x40 -= l2.z * x10; x40 -= l2.w * x11; x40 -= l3.x * x12; x40 -= l3.y * x13; x40 -= l3.z * x14; x40 -= l3.w * x15; x40 -= l4.x * x16; x40 -= l4.y * x17; x40 -= l4.z * x18; x40 -= l4.w * x19; x40 -= l5.x * x20; x40 -= l5.y * x21; x40 -= l5.z * x22; x40 -= l5.w * x23; x40 -= l6.x * x24; x40 -= l6.y * x25; x40 -= l6.z * x26; x40 -= l6.w * x27; x40 -= l7.x * x28; x40 -= l7.y * x29; x40 -= l7.z * x30; x40 -= l7.w * x31; } __builtin_amdgcn_sched_barrier(0); { const v4f l8 = GDN_L4(40, 8); const v4f l9 = GDN_L4(40, 9); __builtin_amdgcn_sched_barrier(0); x40 -= l8.x * x32; x40 -= l8.y * x33; x40 -= l8.z * x34; x40 -= l8.w * x35; x40 -= l9.x * x36; x40 -= l9.y * x37; x40 -= l9.z * x38; x40 -= l9.w * x39; } __builtin_amdgcn_sched_barrier(0);
        float x41 = GDN_RHS(41); { const v4f l0 = GDN_L4(41, 0); const v4f l1 = GDN_L4(41, 1); const v4f l2 = GDN_L4(41, 2); const v4f l3 = GDN_L4(41, 3); const v4f l4 = GDN_L4(41, 4); const v4f l5 = GDN_L4(41, 5); const v4f l6 = GDN_L4(41, 6); const v4f l7 = GDN_L4(41, 7); __builtin_amdgcn_sched_barrier(0); x41 -= l0.x * x0; x41 -= l0.y * x1; x41 -= l0.z * x2; x41 -= l0.w * x3; x41 -= l1.x * x4; x41 -= l1.y * x5; x41 -= l1.z * x6; x41 -= l1.w * x7; x41 -= l2.x * x8; x41 -= l2.y * x9; x41 -= l2.z * x10; x41 -= l2.w * x11; x41 -= l3.x * x12; x41 -= l3.y * x13; x41 -= l3.z * x14; x41 -= l3.w * x15; x41 -= l4.x * x16; x41 -= l4.y * x17; x41 -= l4.z * x18; x41 -= l4.w * x19; x41 -= l5.x * x20; x41 -= l5.y * x21; x41 -= l5.z * x22; x41 -= l5.w * x23; x41 -= l6.x * x24; x41 -= l6.y * x25; x41 -= l6.z * x26; x41 -= l6.w * x27; x41 -= l7.x * x28; x41 -= l7.y * x29; x41 -= l7.z * x30; x41 -= l7.w * x31; } __builtin_amdgcn_sched_barrier(0); { const v4f l8 = GDN_L4(41, 8); const v4f l9 = GDN_L4(41, 9); const v4f l10 = GDN_L4(41, 10); __builtin_amdgcn_sched_barrier(0); x41 -= l8.x * x32; x41 -= l8.y * x33; x41 -= l8.z * x34; x41 -= l8.w * x35; x41 -= l9.x * x36; x41 -= l9.y * x37; x41 -= l9.z * x38; x41 -= l9.w * x39; x41 -= l10.x * x40; } __builtin_amdgcn_sched_barrier(0);
        float x42 = GDN_RHS(42); { const v4f l0 = GDN_L4(42, 0); const v4f l1 = GDN_L4(42, 1); const v4f l2 = GDN_L4(42, 2); const v4f l3 = GDN_L4(42, 3); const v4f l4 = GDN_L4(42, 4); const v4f l5 = GDN_L4(42, 5); const v4f l6 = GDN_L4(42, 6); const v4f l7 = GDN_L4(42, 7); __builtin_amdgcn_sched_barrier(0); x42 -= l0.x * x0; x42 -= l0.y * x1; x42 -= l0.z * x2; x42 -= l0.w * x3; x42 -= l1.x * x4; x42 -= l1.y * x5; x42 -= l1.z * x6; x42 -= l1.w * x7; x42 -= l2.x * x8; x42 -= l2.y * x9; x42 -= l2.z * x10; x42 -= l2.w * x11; x42 -= l3.x * x12; x42 -= l3.y * x13; x42 -= l3.z * x14; x42 -= l3.w * x15; x42 -= l4.x * x16; x42 -= l4.y * x17; x42 -= l4.z * x18; x42 -= l4.w * x19; x42 -= l5.x * x20; x42 -= l5.y * x21; x42 -= l5.z * x22; x42 -= l5.w * x23; x42 -= l6.x * x24; x42 -= l6.y * x25; x42 -= l6.z * x26; x42 -= l6.w * x27; x42 -= l7.x * x28; x42 -= l7.y * x29; x42 -= l7.z * x30; x42 -= l7.w * x31; } __builtin_amdgcn_sched_barrier(0); { const v4f l8 = GDN_L4(42, 8); const v4f l9 = GDN_L4(42, 9); const v4f l10 = GDN_L4(42, 10); __builtin_amdgcn_sched_barrier(0); x42 -= l8.x * x32; x42 -= l8.y * x33; x42 -= l8.z * x34; x42 -= l8.w * x35; x42 -= l9.x * x36; x42 -= l9.y * x37; x42 -= l9.z * x38; x42 -= l9.w * x39; x42 -= l10.x * x40; x42 -= l10.y * x41; } __builtin_amdgcn_sched_barrier(0);
        float x43 = GDN_RHS(43); { const v4f l0 = GDN_L4(43, 0); const v4f l1 = GDN_L4(43, 1); const v4f l2 = GDN_L4(43, 2); const v4f l3 = GDN_L4(43, 3); const v4f l4 = GDN_L4(43, 4); const v4f l5 = GDN_L4(43, 5); const v4f l6 = GDN_L4(43, 6); const v4f l7 = GDN_L4(43, 7); __builtin_amdgcn_sched_barrier(0); x43 -= l0.x * x0; x43 -= l0.y * x1; x43 -= l0.z * x2; x43 -= l0.w * x3; x43 -= l1.x * x4; x43 -= l1.y * x5; x43 -= l1.z * x6; x43 -= l1.w * x7; x43 -= l2.x * x8; x43 -= l2.y * x9; x43 -= l2.z * x10; x43 -= l2.w * x11; x43 -= l3.x * x12; x43 -= l3.y * x13; x43 -= l3.z * x14; x43 -= l3.w * x15; x43 -= l4.x * x16; x43 -= l4.y * x17; x43 -= l4.z * x18; x43 -= l4.w * x19; x43 -= l5.x * x20; x43 -= l5.y * x21; x43 -= l5.z * x22; x43 -= l5.w * x23; x43 -= l6.x * x24; x43 -= l6.y * x25; x43 -= l6.z * x26; x43 -= l6.w * x27; x43 -= l7.x * x28; x43 -= l7.y * x29; x43 -= l7.z * x30; x43 -= l7.w * x31; } __builtin_amdgcn_sched_barrier(0); { const v4f l8 = GDN_L4(43, 8); const v4f l9 = GDN_L4(43, 9); const v4f l10 = GDN_L4(43, 10); __builtin_amdgcn_sched_barrier(0); x43 -= l8.x * x32; x43 -= l8.y * x33; x43 -= l8.z * x34; x43 -= l8.w * x35; x43 -= l9.x * x36; x43 -= l9.y * x37; x43 -= l9.z * x38; x43 -= l9.w * x39; x43 -= l10.x * x40; x43 -= l10.y * x41; x43 -= l10.z * x42; } __builtin_amdgcn_sched_barrier(0);
        float x44 = GDN_RHS(44); { const v4f l0 = GDN_L4(44, 0); const v4f l1 = GDN_L4(44, 1); const v4f l2 = GDN_L4(44, 2); const v4f l3 = GDN_L4(44, 3); const v4f l4 = GDN_L4(44, 4); const v4f l5 = GDN_L4(44, 5); const v4f l6 = GDN_L4(44, 6); const v4f l7 = GDN_L4(44, 7); __builtin_amdgcn_sched_barrier(0); x44 -= l0.x * x0; x44 -= l0.y * x1; x44 -= l0.z * x2; x44 -= l0.w * x3; x44 -= l1.x * x4; x44 -= l1.y * x5; x44 -= l1.z * x6; x44 -= l1.w * x7; x44 -= l2.x * x8; x44 -= l2.y * x9; x44 -= l2.z * x10; x44 -= l2.w * x11; x44 -= l3.x * x12; x44 -= l3.y * x13; x44 -= l3.z * x14; x44 -= l3.w * x15; x44 -= l4.x * x16; x44 -= l4.y * x17; x44 -= l4.z * x18; x44 -= l4.w * x19; x44 -= l5.x * x20; x44 -= l5.y * x21; x44 -= l5.z * x22; x44 -= l5.w * x23; x44 -= l6.x * x24; x44 -= l6.y * x25; x44 -= l6.z * x26; x44 -= l6.w * x27; x44 -= l7.x * x28; x44 -= l7.y * x29; x44 -= l7.z * x30; x44 -= l7.w * x31; } __builtin_amdgcn_sched_barrier(0); { const v4f l8 = GDN_L4(44, 8); const v4f l9 = GDN_L4(44, 9); const v4f l10 = GDN_L4(44, 10); __builtin_amdgcn_sched_barrier(0); x44 -= l8.x * x32; x44 -= l8.y * x33; x44 -= l8.z * x34; x44 -= l8.w * x35; x44 -= l9.x * x36; x44 -= l9.y * x37; x44 -= l9.z * x38; x44 -= l9.w * x39; x44 -= l10.x * x40; x44 -= l10.y * x41; x44 -= l10.z * x42; x44 -= l10.w * x43; } __builtin_amdgcn_sched_barrier(0);
        float x45 = GDN_RHS(45); { const v4f l0 = GDN_L4(45, 0); const v4f l1 = GDN_L4(45, 1); const v4f l2 = GDN_L4(45, 2); const v4f l3 = GDN_L4(45, 3); const v4f l4 = GDN_L4(45, 4); const v4f l5 = GDN_L4(45, 5); const v4f l6 = GDN_L4(45, 6); const v4f l7 = GDN_L4(45, 7); __builtin_amdgcn_sched_barrier(0); x45 -= l0.x * x0; x45 -= l0.y * x1; x45 -= l0.z * x2; x45 -= l0.w * x3; x45 -= l1.x * x4; x45 -= l1.y * x5; x45 -= l1.z * x6; x45 -= l1.w * x7; x45 -= l2.x * x8; x45 -= l2.y * x9; x45 -= l2.z * x10; x45 -= l2.w * x11; x45 -= l3.x * x12; x45 -= l3.y * x13; x45 -= l3.z * x14; x45 -= l3.w * x15; x45 -= l4.x * x16; x45 -= l4.y * x17; x45 -= l4.z * x18; x45 -= l4.w * x19; x45 -= l5.x * x20; x45 -= l5.y * x21; x45 -= l5.z * x22; x45 -= l5.w * x23; x45 -= l6.x * x24; x45 -= l6.y * x25; x45 -= l6.z * x26; x45 -= l6.w * x27; x45 -= l7.x * x28; x45 -= l7.y * x29; x45 -= l7.z * x30; x45 -= l7.w * x31; } __builtin_amdgcn_sched_barrier(0); { const v4f l8 = GDN_L4(45, 8); const v4f l9 = GDN_L4(45, 9); const v4f l10 = GDN_L4(45, 10); const v4f l11 = GDN_L4(45, 11); __builtin_amdgcn_sched_barrier(0); x45 -= l8.x * x32; x45 -= l8.y * x33; x45 -= l8.z * x34; x45 -= l8.w * x35; x45 -= l9.x * x36; x45 -= l9.y * x37; x45 -= l9.z * x38; x45 -= l9.w * x39; x45 -= l10.x * x40; x45 -= l10.y * x41; x45 -= l10.z * x42; x45 -= l10.w * x43; x45 -= l11.x * x44; } __builtin_amdgcn_sched_barrier(0);
        float x46 = GDN_RHS(46); { const v4f l0 = GDN_L4(46, 0); const v4f l1 = GDN_L4(46, 1); const v4f l2 = GDN_L4(46, 2); const v4f l3 = GDN_L4(46, 3); const v4f l4 = GDN_L4(46, 4); const v4f l5 = GDN_L4(46, 5); const v4f l6 = GDN_L4(46, 6); const v4f l7 = GDN_L4(46, 7); __builtin_amdgcn_sched_barrier(0); x46 -= l0.x * x0; x46 -= l0.y * x1; x46 -= l0.z * x2; x46 -= l0.w * x3; x46 -= l1.x * x4; x46 -= l1.y * x5; x46 -= l1.z * x6; x46 -= l1.w * x7; x46 -= l2.x * x8; x46 -= l2.y * x9; x46 -= l2.z * x10; x46 -= l2.w * x11; x46 -= l3.x * x12; x46 -= l3.y * x13; x46 -= l3.z * x14; x46 -= l3.w * x15; x46 -= l4.x * x16; x46 -= l4.y * x17; x46 -= l4.z * x18; x46 -= l4.w * x19; x46 -= l5.x * x20; x46 -= l5.y * x21; x46 -= l5.z * x22; x46 -= l5.w * x23; x46 -= l6.x * x24; x46 -= l6.y * x25; x46 -= l6.z * x26; x46 -= l6.w * x27; x46 -= l7.x * x28; x46 -= l7.y * x29; x46 -= l7.z * x30; x46 -= l7.w * x31; } __builtin_amdgcn_sched_barrier(0); { const v4f l8 = GDN_L4(46, 8); const v4f l9 = GDN_L4(46, 9); const v4f l10 = GDN_L4(46, 10); const v4f l11 = GDN_L4(46, 11); __builtin_amdgcn_sched_barrier(0); x46 -= l8.x * x32; x46 -= l8.y * x33; x46 -= l8.z * x34; x46 -= l8.w * x35; x46 -= l9.x * x36; x46 -= l9.y * x37; x46 -= l9.z * x38; x46 -= l9.w * x39; x46 -= l10.x * x40; x46 -= l10.y * x41; x46 -= l10.z * x42; x46 -= l10.w * x43; x46 -= l11.x * x44; x46 -= l11.y * x45; } __builtin_amdgcn_sched_barrier(0);
        float x47 = GDN_RHS(47); { const v4f l0 = GDN_L4(47, 0); const v4f l1 = GDN_L4(47, 1); const v4f l2 = GDN_L4(47, 2); const v4f l3 = GDN_L4(47, 3); const v4f l4 = GDN_L4(47, 4); const v4f l5 = GDN_L4(47, 5); const v4f l6 = GDN_L4(47, 6); const v4f l7 = GDN_L4(47, 7); __builtin_amdgcn_sched_barrier(0); x47 -= l0.x * x0; x47 -= l0.y * x1; x47 -= l0.z * x2; x47 -= l0.w * x3; x47 -= l1.x * x4; x47 -= l1.y * x5; x47 -= l1.z * x6; x47 -= l1.w * x7; x47 -= l2.x * x8; x47 -= l2.y * x9; x47 -= l2.z * x10; x47 -= l2.w * x11; x47 -= l3.x * x12; x47 -= l3.y * x13; x47 -= l3.z * x14; x47 -= l3.w * x15; x47 -= l4.x * x16; x47 -= l4.y * x17; x47 -= l4.z * x18; x47 -= l4.w * x19; x47 -= l5.x * x20; x47 -= l5.y * x21; x47 -= l5.z * x22; x47 -= l5.w * x23; x47 -= l6.x * x24; x47 -= l6.y * x25; x47 -= l6.z * x26; x47 -= l6.w * x27; x47 -= l7.x * x28; x47 -= l7.y * x29; x47 -= l7.z * x30; x47 -= l7.w * x31; } __builtin_amdgcn_sched_barrier(0); { const v4f l8 = GDN_L4(47, 8); const v4f l9 = GDN_L4(47, 9); const v4f l10 = GDN_L4(47, 10); const v4f l11 = GDN_L4(47, 11); __builtin_amdgcn_sched_barrier(0); x47 -= l8.x * x32; x47 -= l8.y * x33; x47 -= l8.z * x34; x47 -= l8.w * x35; x47 -= l9.x * x36; x47 -= l9.y * x37; x47 -= l9.z * x38; x47 -= l9.w * x39; x47 -= l10.x * x40; x47 -= l10.y * x41; x47 -= l10.z * x42; x47 -= l10.w * x43; x47 -= l11.x * x44; x47 -= l11.y * x45; x47 -= l11.z * x46; } __builtin_amdgcn_sched_barrier(0);
        float x48 = GDN_RHS(48); { const v4f l0 = GDN_L4(48, 0); const v4f l1 = GDN_L4(48, 1); const v4f l2 = GDN_L4(48, 2); const v4f l3 = GDN_L4(48, 3); const v4f l4 = GDN_L4(48, 4); const v4f l5 = GDN_L4(48, 5); const v4f l6 = GDN_L4(48, 6); const v4f l7 = GDN_L4(48, 7); __builtin_amdgcn_sched_barrier(0); x48 -= l0.x * x0; x48 -= l0.y * x1; x48 -= l0.z * x2; x48 -= l0.w * x3; x48 -= l1.x * x4; x48 -= l1.y * x5; x48 -= l1.z * x6; x48 -= l1.w * x7; x48 -= l2.x * x8; x48 -= l2.y * x9; x48 -= l2.z * x10; x48 -= l2.w * x11; x48 -= l3.x * x12; x48 -= l3.y * x13; x48 -= l3.z * x14; x48 -= l3.w * x15; x48 -= l4.x * x16; x48 -= l4.y * x17; x48 -= l4.z * x18; x48 -= l4.w * x19; x48 -= l5.x * x20; x48 -= l5.y * x21; x48 -= l5.z * x22; x48 -= l5.w * x23; x48 -= l6.x * x24; x48 -= l6.y * x25; x48 -= l6.z * x26; x48 -= l6.w * x27; x48 -= l7.x * x28; x48 -= l7.y * x29; x48 -= l7.z * x30; x48 -= l7.w * x31; } __builtin_amdgcn_sched_barrier(0); { const v4f l8 = GDN_L4(48, 8); const v4f l9 = GDN_L4(48, 9); const v4f l10 = GDN_L4(48, 10); const v4f l11 = GDN_L4(48, 11); __builtin_amdgcn_sched_barrier(0); x48 -= l8.x * x32; x48 -= l8.y * x33; x48 -= l8.z * x34; x48 -= l8.w * x35; x48 -= l9.x * x36; x48 -= l9.y * x37; x48 -= l9.z * x38; x48 -= l9.w * x39; x48 -= l10.x * x40; x48 -= l10.y * x41; x48 -= l10.z * x42; x48 -= l10.w * x43; x48 -= l11.x * x44; x48 -= l11.y * x45; x48 -= l11.z * x46; x48 -= l11.w * x47; } __builtin_amdgcn_sched_barrier(0);
        float x49 = GDN_RHS(49); { const v4f l0 = GDN_L4(49, 0); const v4f l1 = GDN_L4(49, 1); const v4f l2 = GDN_L4(49, 2); const v4f l3 = GDN_L4(49, 3); const v4f l4 = GDN_L4(49, 4); const v4f l5 = GDN_L4(49, 5); const v4f l6 = GDN_L4(49, 6); const v4f l7 = GDN_L4(49, 7); __builtin_amdgcn_sched_barrier(0); x49 -= l0.x * x0; x49 -= l0.y * x1; x49 -= l0.z * x2; x49 -= l0.w * x3; x49 -= l1.x * x4; x49 -= l1.y * x5; x49 -= l1.z * x6; x49 -= l1.w * x7; x49 -= l2.x * x8; x49 -= l2.y * x9; x49 -= l2.z * x10; x49 -= l2.w * x11; x49 -= l3.x * x12; x49 -= l3.y * x13; x49 -= l3.z * x14; x49 -= l3.w * x15; x49 -= l4.x * x16; x49 -= l4.y * x17; x49 -= l4.z * x18; x49 -= l4.w * x19; x49 -= l5.x * x20; x49 -= l5.y * x21; x49 -= l5.z * x22; x49 -= l5.w * x23; x49 -= l6.x * x24; x49 -= l6.y * x25; x49 -= l6.z * x26; x49 -= l6.w * x27; x49 -= l7.x * x28; x49 -= l7.y * x29; x49 -= l7.z * x30; x49 -= l7.w * x31; } __builtin_amdgcn_sched_barrier(0); { const v4f l8 = GDN_L4(49, 8); const v4f l9 = GDN_L4(49, 9); const v4f l10 = GDN_L4(49, 10); const v4f l11 = GDN_L4(49, 11); const v4f l12 = GDN_L4(49, 12); __builtin_amdgcn_sched_barrier(0); x49 -= l8.x * x32; x49 -= l8.y * x33; x49 -= l8.z * x34; x49 -= l8.w * x35; x49 -= l9.x * x36; x49 -= l9.y * x37; x49 -= l9.z * x38; x49 -= l9.w * x39; x49 -= l10.x * x40; x49 -= l10.y * x41; x49 -= l10.z * x42; x49 -= l10.w * x43; x49 -= l11.x * x44; x49 -= l11.y * x45; x49 -= l11.z * x46; x49 -= l11.w * x47; x49 -= l12.x * x48; } __builtin_amdgcn_sched_barrier(0);
        float x50 = GDN_RHS(50); { const v4f l0 = GDN_L4(50, 0); const v4f l1 = GDN_L4(50, 1); const v4f l2 = GDN_L4(50, 2); const v4f l3 = GDN_L4(50, 3); const v4f l4 = GDN_L4(50, 4); const v4f l5 = GDN_L4(50, 5); const v4f l6 = GDN_L4(50, 6); const v4f l7 = GDN_L4(50, 7); __builtin_amdgcn_sched_barrier(0); x50 -= l0.x * x0; x50 -= l0.y * x1; x50 -= l0.z * x2; x50 -= l0.w * x3; x50 -= l1.x * x4; x50 -= l1.y * x5; x50 -= l1.z * x6; x50 -= l1.w * x7; x50 -= l2.x * x8; x50 -= l2.y * x9; x50 -= l2.z * x10; x50 -= l2.w * x11; x50 -= l3.x * x12; x50 -= l3.y * x13; x50 -= l3.z * x14; x50 -= l3.w * x15; x50 -= l4.x * x16; x50 -= l4.y * x17; x50 -= l4.z * x18; x50 -= l4.w * x19; x50 -= l5.x * x20; x50 -= l5.y * x21; x50 -= l5.z * x22; x50 -= l5.w * x23; x50 -= l6.x * x24; x50 -= l6.y * x25; x50 -= l6.z * x26; x50 -= l6.w * x27; x50 -= l7.x * x28; x50 -= l7.y * x29; x50 -= l7.z * x30; x50 -= l7.w * x31; } __builtin_amdgcn_sched_barrier(0); { const v4f l8 = GDN_L4(50, 8); const v4f l9 = GDN_L4(50, 9); const v4f l10 = GDN_L4(50, 10); const v4f l11 = GDN_L4(50, 11); const v4f l12 = GDN_L4(50, 12); __builtin_amdgcn_sched_barrier(0); x50 -= l8.x * x32; x50 -= l8.y * x33; x50 -= l8.z * x34; x50 -= l8.w * x35; x50 -= l9.x * x36; x50 -= l9.y * x37; x50 -= l9.z * x38; x50 -= l9.w * x39; x50 -= l10.x * x40; x50 -= l10.y * x41; x50 -= l10.z * x42; x50 -= l10.w * x43; x50 -= l11.x * x44; x50 -= l11.y * x45; x50 -= l11.z * x46; x50 -= l11.w * x47; x50 -= l12.x * x48; x50 -= l12.y * x49; } __builtin_amdgcn_sched_barrier(0);
        float x51 = GDN_RHS(51); { const v4f l0 = GDN_L4(51, 0); const v4f l1 = GDN_L4(51, 1); const v4f l2 = GDN_L4(51, 2); const v4f l3 = GDN_L4(51, 3); const v4f l4 = GDN_L4(51, 4); const v4f l5 = GDN_L4(51, 5); const v4f l6 = GDN_L4(51, 6); const v4f l7 = GDN_L4(51, 7); __builtin_amdgcn_sched_barrier(0); x51 -= l0.x * x0; x51 -= l0.y * x1; x51 -= l0.z * x2; x51 -= l0.w * x3; x51 -= l1.x * x4; x51 -= l1.y * x5; x51 -= l1.z * x6; x51 -= l1.w * x7; x51 -= l2.x * x8; x51 -= l2.y * x9; x51 -= l2.z * x10; x51 -= l2.w * x11; x51 -= l3.x * x12; x51 -= l3.y * x13; x51 -= l3.z * x14; x51 -= l3.w * x15; x51 -= l4.x * x16; x51 -= l4.y * x17; x51 -= l4.z * x18; x51 -= l4.w * x19; x51 -= l5.x * x20; x51 -= l5.y * x21; x51 -= l5.z * x22; x51 -= l5.w * x23; x51 -= l6.x * x24; x51 -= l6.y * x25; x51 -= l6.z * x26; x51 -= l6.w * x27; x51 -= l7.x * x28; x51 -= l7.y * x29; x51 -= l7.z * x30; x51 -= l7.w * x31; } __builtin_amdgcn_sched_barrier(0); { const v4f l8 = GDN_L4(51, 8); const v4f l9 = GDN_L4(51, 9); const v4f l10 = GDN_L4(51, 10); const v4f l11 = GDN_L4(51, 11); const v4f l12 = GDN_L4(51, 12); __builtin_amdgcn_sched_barrier(0); x51 -= l8.x * x32; x51 -= l8.y * x33; x51 -= l8.z * x34; x51 -= l8.w * x35; x51 -= l9.x * x36; x51 -= l9.y * x37; x51 -= l9.z * x38; x51 -= l9.w * x39; x51 -= l10.x * x40; x51 -= l10.y * x41; x51 -= l10.z * x42; x51 -= l10.w * x43; x51 -= l11.x * x44; x51 -= l11.y * x45; x51 -= l11.z * x46; x51 -= l11.w * x47; x51 -= l12.x * x48; x51 -= l12.y * x49; x51 -= l12.z * x50; } __builtin_amdgcn_sched_barrier(0);
        float x52 = GDN_RHS(52); { const v4f l0 = GDN_L4(52, 0); const v4f l1 = GDN_L4(52, 1); const v4f l2 = GDN_L4(52, 2); const v4f l3 = GDN_L4(52, 3); const v4f l4 = GDN_L4(52, 4); const v4f l5 = GDN_L4(52, 5); const v4f l6 = GDN_L4(52, 6); const v4f l7 = GDN_L4(52, 7); __builtin_amdgcn_sched_barrier(0); x52 -= l0.x * x0; x52 -= l0.y * x1; x52 -= l0.z * x2; x52 -= l0.w * x3; x52 -= l1.x * x4; x52 -= l1.y * x5; x52 -= l1.z * x6; x52 -= l1.w * x7; x52 -= l2.x * x8; x52 -= l2.y * x9; x52 -= l2.z * x10; x52 -= l2.w * x11; x52 -= l3.x * x12; x52 -= l3.y * x13; x52 -= l3.z * x14; x52 -= l3.w * x15; x52 -= l4.x * x16; x52 -= l4.y * x17; x52 -= l4.z * x18; x52 -= l4.w * x19; x52 -= l5.x * x20; x52 -= l5.y * x21; x52 -= l5.z * x22; x52 -= l5.w * x23; x52 -= l6.x * x24; x52 -= l6.y * x25; x52 -= l6.z * x26; x52 -= l6.w * x27; x52 -= l7.x * x28; x52 -= l7.y * x29; x52 -= l7.z * x30; x52 -= l7.w * x31; } __builtin_amdgcn_sched_barrier(0); { const v4f l8 = GDN_L4(52, 8); const v4f l9 = GDN_L4(52, 9); const v4f l10 = GDN_L4(52, 10); const v4f l11 = GDN_L4(52, 11); const v4f l12 = GDN_L4(52, 12); __builtin_amdgcn_sched_barrier(0); x52 -= l8.x * x32; x52 -= l8.y * x33; x52 -= l8.z * x34; x52 -= l8.w * x35; x52 -= l9.x * x36; x52 -= l9.y * x37; x52 -= l9.z * x38; x52 -= l9.w * x39; x52 -= l10.x * x40; x52 -= l10.y * x41; x52 -= l10.z * x42; x52 -= l10.w * x43; x52 -= l11.x * x44; x52 -= l11.y * x45; x52 -= l11.z * x46; x52 -= l11.w * x47; x52 -= l12.x * x48; x52 -= l12.y * x49; x52 -= l12.z * x50; x52 -= l12.w * x51; } __builtin_amdgcn_sched_barrier(0);
        float x53 = GDN_RHS(53); { const v4f l0 = GDN_L4(53, 0); const v4f l1 = GDN_L4(53, 1); const v4f l2 = GDN_L4(53, 2); const v4f l3 = GDN_L4(53, 3); const v4f l4 = GDN_L4(53, 4); const v4f l5 = GDN_L4(53, 5); const v4f l6 = GDN_L4(53, 6); const v4f l7 = GDN_L4(53, 7); __builtin_amdgcn_sched_barrier(0); x53 -= l0.x * x0; x53 -= l0.y * x1; x53 -= l0.z * x2; x53 -= l0.w * x3; x53 -= l1.x * x4; x53 -= l1.y * x5; x53 -= l1.z * x6; x53 -= l1.w * x7; x53 -= l2.x * x8; x53 -= l2.y * x9; x53 -= l2.z * x10; x53 -= l2.w * x11; x53 -= l3.x * x12; x53 -= l3.y * x13; x53 -= l3.z * x14; x53 -= l3.w * x15; x53 -= l4.x * x16; x53 -= l4.y * x17; x53 -= l4.z * x18; x53 -= l4.w * x19; x53 -= l5.x * x20; x53 -= l5.y * x21; x53 -= l5.z * x22; x53 -= l5.w * x23; x53 -= l6.x * x24; x53 -= l6.y * x25; x53 -= l6.z * x26; x53 -= l6.w * x27; x53 -= l7.x * x28; x53 -= l7.y * x29; x53 -= l7.z * x30; x53 -= l7.w * x31; } __builtin_amdgcn_sched_barrier(0); { const v4f l8 = GDN_L4(53, 8); const v4f l9 = GDN_L4(53, 9); const v4f l10 = GDN_L4(53, 10); const v4f l11 = GDN_L4(53, 11); const v4f l12 = GDN_L4(53, 12); const v4f l13 = GDN_L4(53, 13); __builtin_amdgcn_sched_barrier(0); x53 -= l8.x * x32; x53 -= l8.y * x33; x53 -= l8.z * x34; x53 -= l8.w * x35; x53 -= l9.x * x36; x53 -= l9.y * x37; x53 -= l9.z * x38; x53 -= l9.w * x39; x53 -= l10.x * x40; x53 -= l10.y * x41; x53 -= l10.z * x42; x53 -= l10.w * x43; x53 -= l11.x * x44; x53 -= l11.y * x45; x53 -= l11.z * x46; x53 -= l11.w * x47; x53 -= l12.x * x48; x53 -= l12.y * x49; x53 -= l12.z * x50; x53 -= l12.w * x51; x53 -= l13.x * x52; } __builtin_amdgcn_sched_barrier(0);
        float x54 = GDN_RHS(54); { const v4f l0 = GDN_L4(54, 0); const v4f l1 = GDN_L4(54, 1); const v4f l2 = GDN_L4(54, 2); const v4f l3 = GDN_L4(54, 3); const v4f l4 = GDN_L4(54, 4); const v4f l5 = GDN_L4(54, 5); const v4f l6 = GDN_L4(54, 6); const v4f l7 = GDN_L4(54, 7); __builtin_amdgcn_sched_barrier(0); x54 -= l0.x * x0; x54 -= l0.y * x1; x54 -= l0.z * x2; x54 -= l0.w * x3; x54 -= l1.x * x4; x54 -= l1.y * x5; x54 -= l1.z * x6; x54 -= l1.w * x7; x54 -= l2.x * x8; x54 -= l2.y * x9; x54 -= l2.z * x10; x54 -= l2.w * x11; x54 -= l3.x * x12; x54 -= l3.y * x13; x54 -= l3.z * x14; x54 -= l3.w * x15; x54 -= l4.x * x16; x54 -= l4.y * x17; x54 -= l4.z * x18; x54 -= l4.w * x19; x54 -= l5.x * x20; x54 -= l5.y * x21; x54 -= l5.z * x22; x54 -= l5.w * x23; x54 -= l6.x * x24; x54 -= l6.y * x25; x54 -= l6.z * x26; x54 -= l6.w * x27; x54 -= l7.x * x28; x54 -= l7.y * x29; x54 -= l7.z * x30; x54 -= l7.w * x31; } __builtin_amdgcn_sched_barrier(0); { const v4f l8 = GDN_L4(54, 8); const v4f l9 = GDN_L4(54, 9); const v4f l10 = GDN_L4(54, 10); const v4f l11 = GDN_L4(54, 11); const v4f l12 = GDN_L4(54, 12); const v4f l13 = GDN_L4(54, 13); __builtin_amdgcn_sched_barrier(0); x54 -= l8.x * x32; x54 -= l8.y * x33; x54 -= l8.z * x34; x54 -= l8.w * x35; x54 -= l9.x * x36; x54 -= l9.y * x37; x54 -= l9.z * x38; x54 -= l9.w * x39; x54 -= l10.x * x40; x54 -= l10.y * x41; x54 -= l10.z * x42; x54 -= l10.w * x43; x54 -= l11.x * x44; x54 -= l11.y * x45; x54 -= l11.z * x46; x54 -= l11.w * x47; x54 -= l12.x * x48; x54 -= l12.y * x49; x54 -= l12.z * x50; x54 -= l12.w * x51; x54 -= l13.x * x52; x54 -= l13.y * x53; } __builtin_amdgcn_sched_barrier(0);
        float x55 = GDN_RHS(55); { const v4f l0 = GDN_L4(55, 0); const v4f l1 = GDN_L4(55, 1); const v4f l2 = GDN_L4(55, 2); const v4f l3 = GDN_L4(55, 3); const v4f l4 = GDN_L4(55, 4); const v4f l5 = GDN_L4(55, 5); const v4f l6 = GDN_L4(55, 6); const v4f l7 = GDN_L4(55, 7); __builtin_amdgcn_sched_barrier(0); x55 -= l0.x * x0; x55 -= l0.y * x1; x55 -= l0.z * x2; x55 -= l0.w * x3; x55 -= l1.x * x4; x55 -= l1.y * x5; x55 -= l1.z * x6; x55 -= l1.w * x7; x55 -= l2.x * x8; x55 -= l2.y * x9; x55 -= l2.z * x10; x55 -= l2.w * x11; x55 -= l3.x * x12; x55 -= l3.y * x13; x55 -= l3.z * x14; x55 -= l3.w * x15; x55 -= l4.x * x16; x55 -= l4.y * x17; x55 -= l4.z * x18; x55 -= l4.w * x19; x55 -= l5.x * x20; x55 -= l5.y * x21; x55 -= l5.z * x22; x55 -= l5.w * x23; x55 -= l6.x * x24; x55 -= l6.y * x25; x55 -= l6.z * x26; x55 -= l6.w * x27; x55 -= l7.x * x28; x55 -= l7.y * x29; x55 -= l7.z * x30; x55 -= l7.w * x31; } __builtin_amdgcn_sched_barrier(0); { const v4f l8 = GDN_L4(55, 8); const v4f l9 = GDN_L4(55, 9); const v4f l10 = GDN_L4(55, 10); const v4f l11 = GDN_L4(55, 11); const v4f l12 = GDN_L4(55, 12); const v4f l13 = GDN_L4(55, 13); __builtin_amdgcn_sched_barrier(0); x55 -= l8.x * x32; x55 -= l8.y * x33; x55 -= l8.z * x34; x55 -= l8.w * x35; x55 -= l9.x * x36; x55 -= l9.y * x37; x55 -= l9.z * x38; x55 -= l9.w * x39; x55 -= l10.x * x40; x55 -= l10.y * x41; x55 -= l10.z * x42; x55 -= l10.w * x43; x55 -= l11.x * x44; x55 -= l11.y * x45; x55 -= l11.z * x46; x55 -= l11.w * x47; x55 -= l12.x * x48; x55 -= l12.y * x49; x55 -= l12.z * x50; x55 -= l12.w * x51; x55 -= l13.x * x52; x55 -= l13.y * x53; x55 -= l13.z * x54; } __builtin_amdgcn_sched_barrier(0);
        float x56 = GDN_RHS(56); { const v4f l0 = GDN_L4(56, 0); const v4f l1 = GDN_L4(56, 1); const v4f l2 = GDN_L4(56, 2); const v4f l3 = GDN_L4(56, 3); const v4f l4 = GDN_L4(56, 4); const v4f l5 = GDN_L4(56, 5); const v4f l6 = GDN_L4(56, 6); const v4f l7 = GDN_L4(56, 7); __builtin_amdgcn_sched_barrier(0); x56 -= l0.x * x0; x56 -= l0.y * x1; x56 -= l0.z * x2; x56 -= l0.w * x3; x56 -= l1.x * x4; x56 -= l1.y * x5; x56 -= l1.z * x6; x56 -= l1.w * x7; x56 -= l2.x * x8; x56 -= l2.y * x9; x56 -= l2.z * x10; x56 -= l2.w * x11; x56 -= l3.x * x12; x56 -= l3.y * x13; x56 -= l3.z * x14; x56 -= l3.w * x15; x56 -= l4.x * x16; x56 -= l4.y * x17; x56 -= l4.z * x18; x56 -= l4.w * x19; x56 -= l5.x * x20; x56 -= l5.y * x21; x56 -= l5.z * x22; x56 -= l5.w * x23; x56 -= l6.x * x24; x56 -= l6.y * x25; x56 -= l6.z * x26; x56 -= l6.w * x27; x56 -= l7.x * x28; x56 -= l7.y * x29; x56 -= l7.z * x30; x56 -= l7.w * x31; } __builtin_amdgcn_sched_barrier(0); { const v4f l8 = GDN_L4(56, 8); const v4f l9 = GDN_L4(56, 9); const v4f l10 = GDN_L4(56, 10); const v4f l11 = GDN_L4(56, 11); const v4f l12 = GDN_L4(56, 12); const v4f l13 = GDN_L4(56, 13); __builtin_amdgcn_sched_barrier(0); x56 -= l8.x * x32; x56 -= l8.y * x33; x56 -= l8.z * x34; x56 -= l8.w * x35; x56 -= l9.x * x36; x56 -= l9.y * x37; x56 -= l9.z * x38; x56 -= l9.w * x39; x56 -= l10.x * x40; x56 -= l10.y * x41; x56 -= l10.z * x42; x56 -= l10.w * x43; x56 -= l11.x * x44; x56 -= l11.y * x45; x56 -= l11.z * x46; x56 -= l11.w * x47; x56 -= l12.x * x48; x56 -= l12.y * x49; x56 -= l12.z * x50; x56 -= l12.w * x51; x56 -= l13.x * x52; x56 -= l13.y * x53; x56 -= l13.z * x54; x56 -= l13.w * x55; } __builtin_amdgcn_sched_barrier(0);
        float x57 = GDN_RHS(57); { const v4f l0 = GDN_L4(57, 0); const v4f l1 = GDN_L4(57, 1); const v4f l2 = GDN_L4(57, 2); const v4f l3 = GDN_L4(57, 3); const v4f l4 = GDN_L4(57, 4); const v4f l5 = GDN_L4(57, 5); const v4f l6 = GDN_L4(57, 6); const v4f l7 = GDN_L4(57, 7); __builtin_amdgcn_sched_barrier(0); x57 -= l0.x * x0; x57 -= l0.y * x1; x57 -= l0.z * x2; x57 -= l0.w * x3; x57 -= l1.x * x4; x57 -= l1.y * x5; x57 -= l1.z * x6; x57 -= l1.w * x7; x57 -= l2.x * x8; x57 -= l2.y * x9; x57 -= l2.z * x10; x57 -= l2.w * x11; x57 -= l3.x * x12; x57 -= l3.y * x13; x57 -= l3.z * x14; x57 -= l3.w * x15; x57 -= l4.x * x16; x57 -= l4.y * x17; x57 -= l4.z * x18; x57 -= l4.w * x19; x57 -= l5.x * x20; x57 -= l5.y * x21; x57 -= l5.z * x22; x57 -= l5.w * x23; x57 -= l6.x * x24; x57 -= l6.y * x25; x57 -= l6.z * x26; x57 -= l6.w * x27; x57 -= l7.x * x28; x57 -= l7.y * x29; x57 -= l7.z * x30; x57 -= l7.w * x31; } __builtin_amdgcn_sched_barrier(0); { const v4f l8 = GDN_L4(57, 8); const v4f l9 = GDN_L4(57, 9); const v4f l10 = GDN_L4(57, 10); const v4f l11 = GDN_L4(57, 11); const v4f l12 = GDN_L4(57, 12); const v4f l13 = GDN_L4(57, 13); const v4f l14 = GDN_L4(57, 14); __builtin_amdgcn_sched_barrier(0); x57 -= l8.x * x32; x57 -= l8.y * x33; x57 -= l8.z * x34; x57 -= l8.w * x35; x57 -= l9.x * x36; x57 -= l9.y * x37; x57 -= l9.z * x38; x57 -= l9.w * x39; x57 -= l10.x * x40; x57 -= l10.y * x41; x57 -= l10.z * x42; x57 -= l10.w * x43; x57 -= l11.x * x44; x57 -= l11.y * x45; x57 -= l11.z * x46; x57 -= l11.w * x47; x57 -= l12.x * x48; x57 -= l12.y * x49; x57 -= l12.z * x50; x57 -= l12.w * x51; x57 -= l13.x * x52; x57 -= l13.y * x53; x57 -= l13.z * x54; x57 -= l13.w * x55; x57 -= l14.x * x56; } __builtin_amdgcn_sched_barrier(0);
        float x58 = GDN_RHS(58); { const v4f l0 = GDN_L4(58, 0); const v4f l1 = GDN_L4(58, 1); const v4f l2 = GDN_L4(58, 2); const v4f l3 = GDN_L4(58, 3); const v4f l4 = GDN_L4(58, 4); const v4f l5 = GDN_L4(58, 5); const v4f l6 = GDN_L4(58, 6); const v4f l7 = GDN_L4(58, 7); __builtin_amdgcn_sched_barrier(0); x58 -= l0.x * x0; x58 -= l0.y * x1; x58 -= l0.z * x2; x58 -= l0.w * x3; x58 -= l1.x * x4; x58 -= l1.y * x5; x58 -= l1.z * x6; x58 -= l1.w * x7; x58 -= l2.x * x8; x58 -= l2.y * x9; x58 -= l2.z * x10; x58 -= l2.w * x11; x58 -= l3.x * x12; x58 -= l3.y * x13; x58 -= l3.z * x14; x58 -= l3.w * x15; x58 -= l4.x * x16; x58 -= l4.y * x17; x58 -= l4.z * x18; x58 -= l4.w * x19; x58 -= l5.x * x20; x58 -= l5.y * x21; x58 -= l5.z * x22; x58 -= l5.w * x23; x58 -= l6.x * x24; x58 -= l6.y * x25; x58 -= l6.z * x26; x58 -= l6.w * x27; x58 -= l7.x * x28; x58 -= l7.y * x29; x58 -= l7.z * x30; x58 -= l7.w * x31; } __builtin_amdgcn_sched_barrier(0); { const v4f l8 = GDN_L4(58, 8); const v4f l9 = GDN_L4(58, 9); const v4f l10 = GDN_L4(58, 10); const v4f l11 = GDN_L4(58, 11); const v4f l12 = GDN_L4(58, 12); const v4f l13 = GDN_L4(58, 13); const v4f l14 = GDN_L4(58, 14); __builtin_amdgcn_sched_barrier(0); x58 -= l8.x * x32; x58 -= l8.y * x33; x58 -= l8.z * x34; x58 -= l8.w * x35; x58 -= l9.x * x36; x58 -= l9.y * x37; x58 -= l9.z * x38; x58 -= l9.w * x39; x58 -= l10.x * x40; x58 -= l10.y * x41; x58 -= l10.z * x42; x58 -= l10.w * x43; x58 -= l11.x * x44; x58 -= l11.y * x45; x58 -= l11.z * x46; x58 -= l11.w * x47; x58 -= l12.x * x48; x58 -= l12.y * x49; x58 -= l12.z * x50; x58 -= l12.w * x51; x58 -= l13.x * x52; x58 -= l13.y * x53; x58 -= l13.z * x54; x58 -= l13.w * x55; x58 -= l14.x * x56; x58 -= l14.y * x57; } __builtin_amdgcn_sched_barrier(0);
        float x59 = GDN_RHS(59); { const v4f l0 = GDN_L4(59, 0); const v4f l1 = GDN_L4(59, 1); const v4f l2 = GDN_L4(59, 2); const v4f l3 = GDN_L4(59, 3); const v4f l4 = GDN_L4(59, 4); const v4f l5 = GDN_L4(59, 5); const v4f l6 = GDN_L4(59, 6); const v4f l7 = GDN_L4(59, 7); __builtin_amdgcn_sched_barrier(0); x59 -= l0.x * x0; x59 -= l0.y * x1; x59 -= l0.z * x2; x59 -= l0.w * x3; x59 -= l1.x * x4; x59 -= l1.y * x5; x59 -= l1.z * x6; x59 -= l1.w * x7; x59 -= l2.x * x8; x59 -= l2.y * x9; x59 -= l2.z * x10; x59 -= l2.w * x11; x59 -= l3.x * x12; x59 -= l3.y * x13; x59 -= l3.z * x14; x59 -= l3.w * x15; x59 -= l4.x * x16; x59 -= l4.y * x17; x59 -= l4.z * x18; x59 -= l4.w * x19; x59 -= l5.x * x20; x59 -= l5.y * x21; x59 -= l5.z * x22; x59 -= l5.w * x23; x59 -= l6.x * x24; x59 -= l6.y * x25; x59 -= l6.z * x26; x59 -= l6.w * x27; x59 -= l7.x * x28; x59 -= l7.y * x29; x59 -= l7.z * x30; x59 -= l7.w * x31; } __builtin_amdgcn_sched_barrier(0); { const v4f l8 = GDN_L4(59, 8); const v4f l9 = GDN_L4(59, 9); const v4f l10 = GDN_L4(59, 10); const v4f l11 = GDN_L4(59, 11); const v4f l12 = GDN_L4(59, 12); const v4f l13 = GDN_L4(59, 13); const v4f l14 = GDN_L4(59, 14); __builtin_amdgcn_sched_barrier(0); x59 -= l8.x * x32; x59 -= l8.y * x33; x59 -= l8.z * x34; x59 -= l8.w * x35; x59 -= l9.x * x36; x59 -= l9.y * x37; x59 -= l9.z * x38; x59 -= l9.w * x39; x59 -= l10.x * x40; x59 -= l10.y * x41; x59 -= l10.z * x42; x59 -= l10.w * x43; x59 -= l11.x * x44; x59 -= l11.y * x45; x59 -= l11.z * x46; x59 -= l11.w * x47; x59 -= l12.x * x48; x59 -= l12.y * x49; x59 -= l12.z * x50; x59 -= l12.w * x51; x59 -= l13.x * x52; x59 -= l13.y * x53; x59 -= l13.z * x54; x59 -= l13.w * x55; x59 -= l14.x * x56; x59 -= l14.y * x57; x59 -= l14.z * x58; } __builtin_amdgcn_sched_barrier(0);
        float x60 = GDN_RHS(60); { const v4f l0 = GDN_L4(60, 0); const v4f l1 = GDN_L4(60, 1); const v4f l2 = GDN_L4(60, 2); const v4f l3 = GDN_L4(60, 3); const v4f l4 = GDN_L4(60, 4); const v4f l5 = GDN_L4(60, 5); const v4f l6 = GDN_L4(60, 6); const v4f l7 = GDN_L4(60, 7); __builtin_amdgcn_sched_barrier(0); x60 -= l0.x * x0; x60 -= l0.y * x1; x60 -= l0.z * x2; x60 -= l0.w * x3; x60 -= l1.x * x4; x60 -= l1.y * x5; x60 -= l1.z * x6; x60 -= l1.w * x7; x60 -= l2.x * x8; x60 -= l2.y * x9; x60 -= l2.z * x10; x60 -= l2.w * x11; x60 -= l3.x * x12; x60 -= l3.y * x13; x60 -= l3.z * x14; x60 -= l3.w * x15; x60 -= l4.x * x16; x60 -= l4.y * x17; x60 -= l4.z * x18; x60 -= l4.w * x19; x60 -= l5.x * x20; x60 -= l5.y * x21; x60 -= l5.z * x22; x60 -= l5.w * x23; x60 -= l6.x * x24; x60 -= l6.y * x25; x60 -= l6.z * x26; x60 -= l6.w * x27; x60 -= l7.x * x28; x60 -= l7.y * x29; x60 -= l7.z * x30; x60 -= l7.w * x31; } __builtin_amdgcn_sched_barrier(0); { const v4f l8 = GDN_L4(60, 8); const v4f l9 = GDN_L4(60, 9); const v4f l10 = GDN_L4(60, 10); const v4f l11 = GDN_L4(60, 11); const v4f l12 = GDN_L4(60, 12); const v4f l13 = GDN_L4(60, 13); const v4f l14 = GDN_L4(60, 14); __builtin_amdgcn_sched_barrier(0); x60 -= l8.x * x32; x60 -= l8.y * x33; x60 -= l8.z * x34; x60 -= l8.w * x35; x60 -= l9.x * x36; x60 -= l9.y * x37; x60 -= l9.z * x38; x60 -= l9.w * x39; x60 -= l10.x * x40; x60 -= l10.y * x41; x60 -= l10.z * x42; x60 -= l10.w * x43; x60 -= l11.x * x44; x60 -= l11.y * x45; x60 -= l11.z * x46; x60 -= l11.w * x47; x60 -= l12.x * x48; x60 -= l12.y * x49; x60 -= l12.z * x50; x60 -= l12.w * x51; x60 -= l13.x * x52; x60 -= l13.y * x53; x60 -= l13.z * x54; x60 -= l13.w * x55; x60 -= l14.x * x56; x60 -= l14.y * x57; x60 -= l14.z * x58; x60 -= l14.w * x59; } __builtin_amdgcn_sched_barrier(0);
        float x61 = GDN_RHS(61); { const v4f l0 = GDN_L4(61, 0); const v4f l1 = GDN_L4(61, 1); const v4f l2 = GDN_L4(61, 2); const v4f l3 = GDN_L4(61, 3); const v4f l4 = GDN_L4(61, 4); const v4f l5 = GDN_L4(61, 5); const v4f l6 = GDN_L4(61, 6); const v4f l7 = GDN_L4(61, 7); __builtin_amdgcn_sched_barrier(0); x61 -= l0.x * x0; x61 -= l0.y * x1; x61 -= l0.z * x2; x61 -= l0.w * x3; x61 -= l1.x * x4; x61 -= l1.y * x5; x61 -= l1.z * x6; x61 -= l1.w * x7; x61 -= l2.x * x8; x61 -= l2.y * x9; x61 -= l2.z * x10; x61 -= l2.w * x11; x61 -= l3.x * x12; x61 -= l3.y * x13; x61 -= l3.z * x14; x61 -= l3.w * x15; x61 -= l4.x * x16; x61 -= l4.y * x17; x61 -= l4.z * x18; x61 -= l4.w * x19; x61 -= l5.x * x20; x61 -= l5.y * x21; x61 -= l5.z * x22; x61 -= l5.w * x23; x61 -= l6.x * x24; x61 -= l6.y * x25; x61 -= l6.z * x26; x61 -= l6.w * x27; x61 -= l7.x * x28; x61 -= l7.y * x29; x61 -= l7.z * x30; x61 -= l7.w * x31; } __builtin_amdgcn_sched_barrier(0); { const v4f l8 = GDN_L4(61, 8); const v4f l9 = GDN_L4(61, 9); const v4f l10 = GDN_L4(61, 10); const v4f l11 = GDN_L4(61, 11); const v4f l12 = GDN_L4(61, 12); const v4f l13 = GDN_L4(61, 13); const v4f l14 = GDN_L4(61, 14); const v4f l15 = GDN_L4(61, 15); __builtin_amdgcn_sched_barrier(0); x61 -= l8.x * x32; x61 -= l8.y * x33; x61 -= l8.z * x34; x61 -= l8.w * x35; x61 -= l9.x * x36; x61 -= l9.y * x37; x61 -= l9.z * x38; x61 -= l9.w * x39; x61 -= l10.x * x40; x61 -= l10.y * x41; x61 -= l10.z * x42; x61 -= l10.w * x43; x61 -= l11.x * x44; x61 -= l11.y * x45; x61 -= l11.z * x46; x61 -= l11.w * x47; x61 -= l12.x * x48; x61 -= l12.y * x49; x61 -= l12.z * x50; x61 -= l12.w * x51; x61 -= l13.x * x52; x61 -= l13.y * x53; x61 -= l13.z * x54; x61 -= l13.w * x55; x61 -= l14.x * x56; x61 -= l14.y * x57; x61 -= l14.z * x58; x61 -= l14.w * x59; x61 -= l15.x * x60; } __builtin_amdgcn_sched_barrier(0);
        float x62 = GDN_RHS(62); { const v4f l0 = GDN_L4(62, 0); const v4f l1 = GDN_L4(62, 1); const v4f l2 = GDN_L4(62, 2); const v4f l3 = GDN_L4(62, 3); const v4f l4 = GDN_L4(62, 4); const v4f l5 = GDN_L4(62, 5); const v4f l6 = GDN_L4(62, 6); const v4f l7 = GDN_L4(62, 7); __builtin_amdgcn_sched_barrier(0); x62 -= l0.x * x0; x62 -= l0.y * x1; x62 -= l0.z * x2; x62 -= l0.w * x3; x62 -= l1.x * x4; x62 -= l1.y * x5; x62 -= l1.z * x6; x62 -= l1.w * x7; x62 -= l2.x * x8; x62 -= l2.y * x9; x62 -= l2.z * x10; x62 -= l2.w * x11; x62 -= l3.x * x12; x62 -= l3.y * x13; x62 -= l3.z * x14; x62 -= l3.w * x15; x62 -= l4.x * x16; x62 -= l4.y * x17; x62 -= l4.z * x18; x62 -= l4.w * x19; x62 -= l5.x * x20; x62 -= l5.y * x21; x62 -= l5.z * x22; x62 -= l5.w * x23; x62 -= l6.x * x24; x62 -= l6.y * x25; x62 -= l6.z * x26; x62 -= l6.w * x27; x62 -= l7.x * x28; x62 -= l7.y * x29; x62 -= l7.z * x30; x62 -= l7.w * x31; } __builtin_amdgcn_sched_barrier(0); { const v4f l8 = GDN_L4(62, 8); const v4f l9 = GDN_L4(62, 9); const v4f l10 = GDN_L4(62, 10); const v4f l11 = GDN_L4(62, 11); const v4f l12 = GDN_L4(62, 12); const v4f l13 = GDN_L4(62, 13); const v4f l14 = GDN_L4(62, 14); const v4f l15 = GDN_L4(62, 15); __builtin_amdgcn_sched_barrier(0); x62 -= l8.x * x32; x62 -= l8.y * x33; x62 -= l8.z * x34; x62 -= l8.w * x35; x62 -= l9.x * x36; x62 -= l9.y * x37; x62 -= l9.z * x38; x62 -= l9.w * x39; x62 -= l10.x * x40; x62 -= l10.y * x41; x62 -= l10.z * x42; x62 -= l10.w * x43; x62 -= l11.x * x44; x62 -= l11.y * x45; x62 -= l11.z * x46; x62 -= l11.w * x47; x62 -= l12.x * x48; x62 -= l12.y * x49; x62 -= l12.z * x50; x62 -= l12.w * x51; x62 -= l13.x * x52; x62 -= l13.y * x53; x62 -= l13.z * x54; x62 -= l13.w * x55; x62 -= l14.x * x56; x62 -= l14.y * x57; x62 -= l14.z * x58; x62 -= l14.w * x59; x62 -= l15.x * x60; x62 -= l15.y * x61; } __builtin_amdgcn_sched_barrier(0);
        float x63 = GDN_RHS(63); { const v4f l0 = GDN_L4(63, 0); const v4f l1 = GDN_L4(63, 1); const v4f l2 = GDN_L4(63, 2); const v4f l3 = GDN_L4(63, 3); const v4f l4 = GDN_L4(63, 4); const v4f l5 = GDN_L4(63, 5); const v4f l6 = GDN_L4(63, 6); const v4f l7 = GDN_L4(63, 7); __builtin_amdgcn_sched_barrier(0); x63 -= l0.x * x0; x63 -= l0.y * x1; x63 -= l0.z * x2; x63 -= l0.w * x3; x63 -= l1.x * x4; x63 -= l1.y * x5; x63 -= l1.z * x6; x63 -= l1.w * x7; x63 -= l2.x * x8; x63 -= l2.y * x9; x63 -= l2.z * x10; x63 -= l2.w * x11; x63 -= l3.x * x12; x63 -= l3.y * x13; x63 -= l3.z * x14; x63 -= l3.w * x15; x63 -= l4.x * x16; x63 -= l4.y * x17; x63 -= l4.z * x18; x63 -= l4.w * x19; x63 -= l5.x * x20; x63 -= l5.y * x21; x63 -= l5.z * x22; x63 -= l5.w * x23; x63 -= l6.x * x24; x63 -= l6.y * x25; x63 -= l6.z * x26; x63 -= l6.w * x27; x63 -= l7.x * x28; x63 -= l7.y * x29; x63 -= l7.z * x30; x63 -= l7.w * x31; } __builtin_amdgcn_sched_barrier(0); { const v4f l8 = GDN_L4(63, 8); const v4f l9 = GDN_L4(63, 9); const v4f l10 = GDN_L4(63, 10); const v4f l11 = GDN_L4(63, 11); const v4f l12 = GDN_L4(63, 12); const v4f l13 = GDN_L4(63, 13); const v4f l14 = GDN_L4(63, 14); const v4f l15 = GDN_L4(63, 15); __builtin_amdgcn_sched_barrier(0); x63 -= l8.x * x32; x63 -= l8.y * x33; x63 -= l8.z * x34; x63 -= l8.w * x35; x63 -= l9.x * x36; x63 -= l9.y * x37; x63 -= l9.z * x38; x63 -= l9.w * x39; x63 -= l10.x * x40; x63 -= l10.y * x41; x63 -= l10.z * x42; x63 -= l10.w * x43; x63 -= l11.x * x44; x63 -= l11.y * x45; x63 -= l11.z * x46; x63 -= l11.w * x47; x63 -= l12.x * x48; x63 -= l12.y * x49; x63 -= l12.z * x50; x63 -= l12.w * x51; x63 -= l13.x * x52; x63 -= l13.y * x53; x63 -= l13.z * x54; x63 -= l13.w * x55; x63 -= l14.x * x56; x63 -= l14.y * x57; x63 -= l14.z * x58; x63 -= l14.w * x59; x63 -= l15.x * x60; x63 -= l15.y * x61; x63 -= l15.z * x62; } __builtin_amdgcn_sched_barrier(0);
        if (c < 128) { GU[0 * 128 + c] = x0; GU[1 * 128 + c] = x1; GU[2 * 128 + c] = x2; GU[3 * 128 + c] = x3; GU[4 * 128 + c] = x4; GU[5 * 128 + c] = x5; GU[6 * 128 + c] = x6; GU[7 * 128 + c] = x7; GU[8 * 128 + c] = x8; GU[9 * 128 + c] = x9; GU[10 * 128 + c] = x10; GU[11 * 128 + c] = x11; GU[12 * 128 + c] = x12; GU[13 * 128 + c] = x13; GU[14 * 128 + c] = x14; GU[15 * 128 + c] = x15; GU[16 * 128 + c] = x16; GU[17 * 128 + c] = x17; GU[18 * 128 + c] = x18; GU[19 * 128 + c] = x19; GU[20 * 128 + c] = x20; GU[21 * 128 + c] = x21; GU[22 * 128 + c] = x22; GU[23 * 128 + c] = x23; GU[24 * 128 + c] = x24; GU[25 * 128 + c] = x25; GU[26 * 128 + c] = x26; GU[27 * 128 + c] = x27; GU[28 * 128 + c] = x28; GU[29 * 128 + c] = x29; GU[30 * 128 + c] = x30; GU[31 * 128 + c] = x31; GU[32 * 128 + c] = x32; GU[33 * 128 + c] = x33; GU[34 * 128 + c] = x34; GU[35 * 128 + c] = x35; GU[36 * 128 + c] = x36; GU[37 * 128 + c] = x37; GU[38 * 128 + c] = x38; GU[39 * 128 + c] = x39; GU[40 * 128 + c] = x40; GU[41 * 128 + c] = x41; GU[42 * 128 + c] = x42; GU[43 * 128 + c] = x43; GU[44 * 128 + c] = x44; GU[45 * 128 + c] = x45; GU[46 * 128 + c] = x46; GU[47 * 128 + c] = x47; GU[48 * 128 + c] = x48; GU[49 * 128 + c] = x49; GU[50 * 128 + c] = x50; GU[51 * 128 + c] = x51; GU[52 * 128 + c] = x52; GU[53 * 128 + c] = x53; GU[54 * 128 + c] = x54; GU[55 * 128 + c] = x55; GU[56 * 128 + c] = x56; GU[57 * 128 + c] = x57; GU[58 * 128 + c] = x58; GU[59 * 128 + c] = x59; GU[60 * 128 + c] = x60; GU[61 * 128 + c] = x61; GU[62 * 128 + c] = x62; GU[63 * 128 + c] = x63; }
        else { GNW[0 * 128 + (c - 128)] = (bf16)f2bf(-x0); GNW[1 * 128 + (c - 128)] = (bf16)f2bf(-x1); GNW[2 * 128 + (c - 128)] = (bf16)f2bf(-x2); GNW[3 * 128 + (c - 128)] = (bf16)f2bf(-x3); GNW[4 * 128 + (c - 128)] = (bf16)f2bf(-x4); GNW[5 * 128 + (c - 128)] = (bf16)f2bf(-x5); GNW[6 * 128 + (c - 128)] = (bf16)f2bf(-x6); GNW[7 * 128 + (c - 128)] = (bf16)f2bf(-x7); GNW[8 * 128 + (c - 128)] = (bf16)f2bf(-x8); GNW[9 * 128 + (c - 128)] = (bf16)f2bf(-x9); GNW[10 * 128 + (c - 128)] = (bf16)f2bf(-x10); GNW[11 * 128 + (c - 128)] = (bf16)f2bf(-x11); GNW[12 * 128 + (c - 128)] = (bf16)f2bf(-x12); GNW[13 * 128 + (c - 128)] = (bf16)f2bf(-x13); GNW[14 * 128 + (c - 128)] = (bf16)f2bf(-x14); GNW[15 * 128 + (c - 128)] = (bf16)f2bf(-x15); GNW[16 * 128 + (c - 128)] = (bf16)f2bf(-x16); GNW[17 * 128 + (c - 128)] = (bf16)f2bf(-x17); GNW[18 * 128 + (c - 128)] = (bf16)f2bf(-x18); GNW[19 * 128 + (c - 128)] = (bf16)f2bf(-x19); GNW[20 * 128 + (c - 128)] = (bf16)f2bf(-x20); GNW[21 * 128 + (c - 128)] = (bf16)f2bf(-x21); GNW[22 * 128 + (c - 128)] = (bf16)f2bf(-x22); GNW[23 * 128 + (c - 128)] = (bf16)f2bf(-x23); GNW[24 * 128 + (c - 128)] = (bf16)f2bf(-x24); GNW[25 * 128 + (c - 128)] = (bf16)f2bf(-x25); GNW[26 * 128 + (c - 128)] = (bf16)f2bf(-x26); GNW[27 * 128 + (c - 128)] = (bf16)f2bf(-x27); GNW[28 * 128 + (c - 128)] = (bf16)f2bf(-x28); GNW[29 * 128 + (c - 128)] = (bf16)f2bf(-x29); GNW[30 * 128 + (c - 128)] = (bf16)f2bf(-x30); GNW[31 * 128 + (c - 128)] = (bf16)f2bf(-x31); GNW[32 * 128 + (c - 128)] = (bf16)f2bf(-x32); GNW[33 * 128 + (c - 128)] = (bf16)f2bf(-x33); GNW[34 * 128 + (c - 128)] = (bf16)f2bf(-x34); GNW[35 * 128 + (c - 128)] = (bf16)f2bf(-x35); GNW[36 * 128 + (c - 128)] = (bf16)f2bf(-x36); GNW[37 * 128 + (c - 128)] = (bf16)f2bf(-x37); GNW[38 * 128 + (c - 128)] = (bf16)f2bf(-x38); GNW[39 * 128 + (c - 128)] = (bf16)f2bf(-x39); GNW[40 * 128 + (c - 128)] = (bf16)f2bf(-x40); GNW[41 * 128 + (c - 128)] = (bf16)f2bf(-x41); GNW[42 * 128 + (c - 128)] = (bf16)f2bf(-x42); GNW[43 * 128 + (c - 128)] = (bf16)f2bf(-x43); GNW[44 * 128 + (c - 128)] = (bf16)f2bf(-x44); GNW[45 * 128 + (c - 128)] = (bf16)f2bf(-x45); GNW[46 * 128 + (c - 128)] = (bf16)f2bf(-x46); GNW[47 * 128 + (c - 128)] = (bf16)f2bf(-x47); GNW[48 * 128 + (c - 128)] = (bf16)f2bf(-x48); GNW[49 * 128 + (c - 128)] = (bf16)f2bf(-x49); GNW[50 * 128 + (c - 128)] = (bf16)f2bf(-x50); GNW[51 * 128 + (c - 128)] = (bf16)f2bf(-x51); GNW[52 * 128 + (c - 128)] = (bf16)f2bf(-x52); GNW[53 * 128 + (c - 128)] = (bf16)f2bf(-x53); GNW[54 * 128 + (c - 128)] = (bf16)f2bf(-x54); GNW[55 * 128 + (c - 128)] = (bf16)f2bf(-x55); GNW[56 * 128 + (c - 128)] = (bf16)f2bf(-x56); GNW[57 * 128 + (c - 128)] = (bf16)f2bf(-x57); GNW[58 * 128 + (c - 128)] = (bf16)f2bf(-x58); GNW[59 * 128 + (c - 128)] = (bf16)f2bf(-x59); GNW[60 * 128 + (c - 128)] = (bf16)f2bf(-x60); GNW[61 * 128 + (c - 128)] = (bf16)f2bf(-x61); GNW[62 * 128 + (c - 128)] = (bf16)f2bf(-x62); GNW[63 * 128 + (c - 128)] = (bf16)f2bf(-x63); }
#undef GDN_RHS
#undef GDN_L4
    } else {
        const int t2 = tid - 256; const float gl = gcs[63];
        { const int i = t2 >> 2, d0 = (t2 & 3) * 32; const float e = __expf(gcs[i]);
#pragma unroll
          for (int x8 = 0; x8 < 4; ++x8) { const v4f a = *(const LAS v4f*)(qs + i * QP + d0 + 8 * x8), b = *(const LAS v4f*)(qs + i * QP + d0 + 8 * x8 + 4);
              v4u w; w.x = pk2(a.x * e, a.y * e); w.y = pk2(a.z * e, a.w * e); w.z = pk2(b.x * e, b.y * e); w.w = pk2(b.z * e, b.w * e); *(v4u*)(GQG + i * 128 + d0 + 8 * x8) = w; } }
        { const int d = t2 >> 1, j0 = (t2 & 1) * 32;
#pragma unroll
          for (int x8 = 0; x8 < 4; ++x8) { float o[8];
#pragma unroll
              for (int x = 0; x < 8; ++x) { const int j = j0 + 8 * x8 + x; o[x] = ks[j * QP + d] * __expf(gl - gcs[j]); }
              v4u w; w.x = pk2(o[0], o[1]); w.y = pk2(o[2], o[3]); w.z = pk2(o[4], o[5]); w.w = pk2(o[6], o[7]); *(v4u*)(GKT + d * 64 + j0 + 8 * x8) = w; } }
        if (t2 == 0) GDL[item] = __expf(gl);
    }
    __syncthreads();
}
struct GdnFrags { bf16x8_t nw[4], qg[4], at[2], kt[2][2]; float u[4]; float dl; };
__device__ __forceinline__ void gdn_load(GdnFrags& F, const Params& p, int item, int off128, int off64, int offk, int offu) {
    const bf16* GNW = (const bf16*)(p.ws + WS_GNW) + (size_t)item * 8192; const bf16* GQG = (const bf16*)(p.ws + WS_GQG) + (size_t)item * 8192;
    const bf16* GAT = (const bf16*)(p.ws + WS_GAT) + (size_t)item * 4096; const bf16* GKT = (const bf16*)(p.ws + WS_GKT) + (size_t)item * 8192; const float* GU = (const float*)(p.ws + WS_GU) + (size_t)item * 8192;
#pragma unroll
    for (int ks = 0; ks < 4; ++ks) { F.nw[ks] = *(const bf16x8_t*)(GNW + off128 + 32 * ks); F.qg[ks] = *(const bf16x8_t*)(GQG + off128 + 32 * ks); }
#pragma unroll
    for (int ks = 0; ks < 2; ++ks) { F.at[ks] = *(const bf16x8_t*)(GAT + off64 + 32 * ks); F.kt[0][ks] = *(const bf16x8_t*)(GKT + offk + 32 * ks); F.kt[1][ks] = *(const bf16x8_t*)(GKT + offk + 1024 + 32 * ks); }
#pragma unroll
    for (int r = 0; r < 4; ++r) F.u[r] = GU[offu + r * 128];
    F.dl = ((const float*)(p.ws + WS_GDL))[item];
}
constexpr int STP = 136, VNP = 72;
__device__ __forceinline__ void gdn_seq(const Params& p, LAS unsigned char* lds, int wgi, int wave, int lane) {
    const int u = wgi * 2 + (wave >> 2), wi = wave & 3, h = u >> 3, sl = u & 7, g = lane >> 4, c = lane & 15;
    LAS unsigned short* ST = (LAS unsigned short*)(lds + (wave >> 2) * 12288);
    LAS unsigned short* VNT = ST + 2 * 16 * STP;
    float* GO = (float*)(p.ws + WS_GO);
    const int off128 = (16 * wi + c) * 128 + 8 * g, off64 = (16 * wi + c) * 64 + 8 * g, offk = (32 * wi + c) * 64 + 8 * g, offu = (16 * wi + 4 * g) * 128 + 16 * sl + c;
#pragma unroll
    for (int mt = 0; mt < 2; ++mt) *(LAS v2u*)(ST + c * STP + 16 * (2 * wi + mt) + 4 * g) = (v2u){0u, 0u};
    pg8::f32x4 Sacc[2] = {{0.f, 0.f, 0.f, 0.f}, {0.f, 0.f, 0.f, 0.f}};
    __syncthreads();
    GdnFrags F0, F1;
    gdn_load(F0, p, h, off128, off64, offk, offu);
#define GDN_STEP(F, n_) do { const int cur = (n_) & 1; bf16x8_t sf[4]; \
        _Pragma("unroll") for (int ks = 0; ks < 4; ++ks) sf[ks] = *(const LAS bf16x8_t*)(ST + cur * 16 * STP + c * STP + 32 * ks + 8 * g); \
        pg8::f32x4 vn = {F.u[0], F.u[1], F.u[2], F.u[3]}; \
        _Pragma("unroll") for (int ks = 0; ks < 4; ++ks) vn = __builtin_amdgcn_mfma_f32_16x16x32_bf16(F.nw[ks], sf[ks], vn, 0, 0, 0); \
        { v2u w; w.x = pk2(vn[0], vn[1]); w.y = pk2(vn[2], vn[3]); *(LAS v2u*)(VNT + c * VNP + 16 * wi + 4 * g) = w; } \
        LDS_BAR(); \
        const bf16x8_t v0 = *(const LAS bf16x8_t*)(VNT + c * VNP + 8 * g), v1 = *(const LAS bf16x8_t*)(VNT + c * VNP + 32 + 8 * g); \
        pg8::f32x4 o = {0.f, 0.f, 0.f, 0.f}; \
        _Pragma("unroll") for (int ks = 0; ks < 4; ++ks) o = __builtin_amdgcn_mfma_f32_16x16x32_bf16(F.qg[ks], sf[ks], o, 0, 0, 0); \
        o = __builtin_amdgcn_mfma_f32_16x16x32_bf16(F.at[0], v0, o, 0, 0, 0); o = __builtin_amdgcn_mfma_f32_16x16x32_bf16(F.at[1], v1, o, 0, 0, 0); \
        { const size_t tb = (size_t)(n_) * 64 + 16 * wi + 4 * g; _Pragma("unroll") for (int r = 0; r < 4; ++r) GO[(tb + r) * BW + h * 128 + 16 * sl + c] = o[r]; } \
        _Pragma("unroll") for (int mt = 0; mt < 2; ++mt) { Sacc[mt] = Sacc[mt] * F.dl; \
            Sacc[mt] = __builtin_amdgcn_mfma_f32_16x16x32_bf16(F.kt[mt][0], v0, Sacc[mt], 0, 0, 0); Sacc[mt] = __builtin_amdgcn_mfma_f32_16x16x32_bf16(F.kt[mt][1], v1, Sacc[mt], 0, 0, 0); \
            v2u w; w.x = pk2(Sacc[mt][0], Sacc[mt][1]); w.y = pk2(Sacc[mt][2], Sacc[mt][3]); *(LAS v2u*)(ST + (cur ^ 1) * 16 * STP + c * STP + 16 * (2 * wi + mt) + 4 * g) = w; } \
        LDS_BAR(); } while (0)
    for (int n = 0; n < T / 64; n += 2) {
        gdn_load(F1, p, (n + 1) * 4 + h, off128, off64, offk, offu);
        GDN_STEP(F0, n);
        gdn_load(F0, p, ((n + 2 < T / 64) ? n + 2 : n) * 4 + h, off128, off64, offk, offu);
        GDN_STEP(F1, n + 1);
    }
#undef GDN_STEP
}

constexpr int SEQ_UOFF = 132096;
constexpr int GI_NW = 0, GI_QG = 8704, GI_AT = 17408, GI_KT = 22016, GI_SZ = 31232;
struct GdnStage { v4u r[7]; float u[4]; float dl; };
__device__ __forceinline__ void gdn_stage_load(GdnStage& Sg, const Params& p, int item, int tid, int offu) {
    const bf16* GNW = (const bf16*)(p.ws + WS_GNW) + (size_t)item * 8192; const bf16* GQG = (const bf16*)(p.ws + WS_GQG) + (size_t)item * 8192;
    const bf16* GAT = (const bf16*)(p.ws + WS_GAT) + (size_t)item * 4096; const bf16* GKT = (const bf16*)(p.ws + WS_GKT) + (size_t)item * 8192; const float* GU = (const float*)(p.ws + WS_GU) + (size_t)item * 8192;
    Sg.r[0] = *(const v4u*)(GNW + 8 * tid); Sg.r[1] = *(const v4u*)(GNW + 8 * (tid + 512)); Sg.r[2] = *(const v4u*)(GQG + 8 * tid); Sg.r[3] = *(const v4u*)(GQG + 8 * (tid + 512));
    Sg.r[4] = *(const v4u*)(GAT + 8 * tid); Sg.r[5] = *(const v4u*)(GKT + 8 * tid); Sg.r[6] = *(const v4u*)(GKT + 8 * (tid + 512));
#pragma unroll
    for (int r = 0; r < 4; ++r) Sg.u[r] = GU[offu + r * 128];
    Sg.dl = ((const float*)(p.ws + WS_GDL))[item];
}
__device__ __forceinline__ void gdn_stage_write(const GdnStage& Sg, LAS unsigned short* img, int tid) {
    { const int p0 = tid, p1 = tid + 512;
      *(LAS v4u*)(img + GI_NW + (p0 >> 4) * 136 + 8 * (p0 & 15)) = Sg.r[0]; *(LAS v4u*)(img + GI_NW + (p1 >> 4) * 136 + 8 * (p1 & 15)) = Sg.r[1];
      *(LAS v4u*)(img + GI_QG + (p0 >> 4) * 136 + 8 * (p0 & 15)) = Sg.r[2]; *(LAS v4u*)(img + GI_QG + (p1 >> 4) * 136 + 8 * (p1 & 15)) = Sg.r[3];
      *(LAS v4u*)(img + GI_AT + (p0 >> 3) * 72 + 8 * (p0 & 7)) = Sg.r[4];
      *(LAS v4u*)(img + GI_KT + (p0 >> 3) * 72 + 8 * (p0 & 7)) = Sg.r[5]; *(LAS v4u*)(img + GI_KT + (p1 >> 3) * 72 + 8 * (p1 & 7)) = Sg.r[6]; }
}
__device__ __forceinline__ void gdn_seq2(const Params& p, LAS unsigned char* lds, int wgi, int tid, int wave, int lane) {
    const int h = wgi >> 2, sl = 2 * (wgi & 3) + (wave >> 2), wi = wave & 3, g = lane >> 4, c = lane & 15;
    LAS unsigned short* IMG = (LAS unsigned short*)lds;
    LAS unsigned short* ST = (LAS unsigned short*)(lds + SEQ_UOFF + (wave >> 2) * 12288);
    LAS unsigned short* VNT = ST + 2 * 16 * STP;
    float* GO = (float*)(p.ws + WS_GO);
    const int offu = (16 * wi + 4 * g) * 128 + 16 * sl + c;
#pragma unroll
    for (int mt = 0; mt < 2; ++mt) *(LAS v2u*)(ST + c * STP + 16 * (2 * wi + mt) + 4 * g) = (v2u){0u, 0u};
    pg8::f32x4 Sacc[2] = {{0.f, 0.f, 0.f, 0.f}, {0.f, 0.f, 0.f, 0.f}};
    GdnStage A, B;
    gdn_stage_load(A, p, h, tid, offu); gdn_stage_write(A, IMG, tid);
    gdn_stage_load(B, p, 4 + h, tid, offu);
    LDS_BAR();
    constexpr int NCH = T / 64;
#define GDN_STEP2(X, Y, n_) do { const int cur = (n_) & 1; const LAS unsigned short* im = IMG + cur * GI_SZ; bf16x8_t sf[4]; \
        _Pragma("unroll") for (int ks = 0; ks < 4; ++ks) sf[ks] = *(const LAS bf16x8_t*)(ST + cur * 16 * STP + c * STP + 32 * ks + 8 * g); \
        pg8::f32x4 vn = {X.u[0], X.u[1], X.u[2], X.u[3]}; const float dl = X.dl; \
        _Pragma("unroll") for (int ks = 0; ks < 4; ++ks) vn = __builtin_amdgcn_mfma_f32_16x16x32_bf16(*(const LAS bf16x8_t*)(im + GI_NW + (16 * wi + c) * 136 + 32 * ks + 8 * g), sf[ks], vn, 0, 0, 0); \
        { v2u w; w.x = pk2(vn[0], vn[1]); w.y = pk2(vn[2], vn[3]); *(LAS v2u*)(VNT + c * VNP + 16 * wi + 4 * g) = w; } \
        pg8::f32x4 o = {0.f, 0.f, 0.f, 0.f}; \
        _Pragma("unroll") for (int ks = 0; ks < 4; ++ks) o = __builtin_amdgcn_mfma_f32_16x16x32_bf16(*(const LAS bf16x8_t*)(im + GI_QG + (16 * wi + c) * 136 + 32 * ks + 8 * g), sf[ks], o, 0, 0, 0); \
        LDS_BAR(); \
        gdn_stage_load(X, p, (((n_) + 2 < NCH) ? (n_) + 2 : (n_)) * 4 + h, tid, offu); \
        const bf16x8_t v0 = *(const LAS bf16x8_t*)(VNT + c * VNP + 8 * g), v1 = *(const LAS bf16x8_t*)(VNT + c * VNP + 32 + 8 * g); \
        o = __builtin_amdgcn_mfma_f32_16x16x32_bf16(*(const LAS bf16x8_t*)(im + GI_AT + (16 * wi + c) * 72 + 8 * g), v0, o, 0, 0, 0); \
        o = __builtin_amdgcn_mfma_f32_16x16x32_bf16(*(const LAS bf16x8_t*)(im + GI_AT + (16 * wi + c) * 72 + 32 + 8 * g), v1, o, 0, 0, 0); \
        { const size_t tb = (size_t)(n_) * 64 + 16 * wi + 4 * g; _Pragma("unroll") for (int r = 0; r < 4; ++r) GO[(tb + r) * BW + h * 128 + 16 * sl + c] = o[r]; } \
        _Pragma("unroll") for (int mt = 0; mt < 2; ++mt) { Sacc[mt] = Sacc[mt] * dl; \
            Sacc[mt] = __builtin_amdgcn_mfma_f32_16x16x32_bf16(*(const LAS bf16x8_t*)(im + GI_KT + (16 * (2 * wi + mt) + c) * 72 + 8 * g), v0, Sacc[mt], 0, 0, 0); \
            Sacc[mt] = __builtin_amdgcn_mfma_f32_16x16x32_bf16(*(const LAS bf16x8_t*)(im + GI_KT + (16 * (2 * wi + mt) + c) * 72 + 32 + 8 * g), v1, Sacc[mt], 0, 0, 0); \
            v2u w; w.x = pk2(Sacc[mt][0], Sacc[mt][1]); w.y = pk2(Sacc[mt][2], Sacc[mt][3]); *(LAS v2u*)(ST + (cur ^ 1) * 16 * STP + c * STP + 16 * (2 * wi + mt) + 4 * g) = w; } \
        gdn_stage_write(Y, IMG + (cur ^ 1) * GI_SZ, tid); \
        LDS_BAR(); } while (0)
    for (int n = 0; n < NCH; n += 2) { GDN_STEP2(A, B, n); GDN_STEP2(B, A, n + 1); }
#undef GDN_STEP2
}
constexpr int MI_Q = 0, MI_S = 4608, MI_K = 9216, MI_SZ = 13824;
struct MlStage { v4u r[3]; bf16x8_t vt[2]; float fl; };
__device__ __forceinline__ void ml_stage_load(MlStage& Sg, const Params& p, int item, int tid, int offV) {
    const bf16* MQ = (const bf16*)(p.ws + WS_MQ) + (size_t)item * 4096; const bf16* MS = (const bf16*)(p.ws + WS_MS) + (size_t)item * 4096; const bf16* MK = (const bf16*)(p.ws + WS_MK) + (size_t)item * 4096;
    const bf16* MV = (const bf16*)(p.ws + WS_MV) + (size_t)item * 9216;
    Sg.r[0] = *(const v4u*)(MQ + 8 * tid); Sg.r[1] = *(const v4u*)(MS + 8 * tid); Sg.r[2] = *(const v4u*)(MK + 8 * tid);
    Sg.vt[0] = *(const bf16x8_t*)(MV + offV); Sg.vt[1] = *(const bf16x8_t*)(MV + offV + 32);
    Sg.fl = ((const float*)(p.ws + WS_MFL))[item];
}
__device__ __forceinline__ void ml_stage_write(const MlStage& Sg, LAS unsigned short* img, int tid) {
    const int o = (tid >> 3) * 72 + 8 * (tid & 7);
    *(LAS v4u*)(img + MI_Q + o) = Sg.r[0]; *(LAS v4u*)(img + MI_S + o) = Sg.r[1]; *(LAS v4u*)(img + MI_K + o) = Sg.r[2];
}
__device__ __forceinline__ void ml_seq2(const Params& p, LAS unsigned char* lds, int wgi, int tid, int wave, int lane) {
    const int h = wgi / 5, sl0 = 2 * (wgi % 5) + (wave >> 2), wi = wave & 3, g = lane >> 4, c = lane & 15;
    const bool real = sl0 < 9; const int sl = real ? sl0 : 8;
    LAS unsigned short* IMG = (LAS unsigned short*)lds;
    LAS unsigned short* CT = (LAS unsigned short*)(lds + SEQ_UOFF + (wave >> 2) * 8192);
    float* HO = (float*)(p.ws + WS_HO); float* HDEN = (float*)(p.ws + WS_HDEN);
    const int offV = (16 * sl + c) * 64 + 8 * g;
    *(LAS v2u*)(CT + c * 72 + 16 * wi + 4 * g) = (v2u){0u, 0u};
    pg8::f32x4 Cacc = {0.f, 0.f, 0.f, 0.f};
    MlStage A, B;
    ml_stage_load(A, p, h, tid, offV); ml_stage_write(A, IMG, tid);
    ml_stage_load(B, p, 4 + h, tid, offV);
    LDS_BAR();
    constexpr int NCH = T / 64;
#define ML_STEP2(X, Y, n_) do { const int cur = (n_) & 1; const LAS unsigned short* im = IMG + cur * MI_SZ; const int ro = (16 * wi + c) * 72 + 8 * g; \
        const bf16x8_t c0 = *(const LAS bf16x8_t*)(CT + cur * 16 * 72 + c * 72 + 8 * g), c1 = *(const LAS bf16x8_t*)(CT + cur * 16 * 72 + c * 72 + 32 + 8 * g); \
        const bf16x8_t vt0 = X.vt[0], vt1 = X.vt[1]; const float fl = X.fl; \
        pg8::f32x4 num = {0.f, 0.f, 0.f, 0.f}; \
        num = __builtin_amdgcn_mfma_f32_16x16x32_bf16(*(const LAS bf16x8_t*)(im + MI_Q + ro), c0, num, 0, 0, 0); num = __builtin_amdgcn_mfma_f32_16x16x32_bf16(*(const LAS bf16x8_t*)(im + MI_Q + ro + 32), c1, num, 0, 0, 0); \
        num = __builtin_amdgcn_mfma_f32_16x16x32_bf16(*(const LAS bf16x8_t*)(im + MI_S + ro), vt0, num, 0, 0, 0); num = __builtin_amdgcn_mfma_f32_16x16x32_bf16(*(const LAS bf16x8_t*)(im + MI_S + ro + 32), vt1, num, 0, 0, 0); \
        Cacc = Cacc * fl; \
        Cacc = __builtin_amdgcn_mfma_f32_16x16x32_bf16(*(const LAS bf16x8_t*)(im + MI_K + ro), vt0, Cacc, 0, 0, 0); Cacc = __builtin_amdgcn_mfma_f32_16x16x32_bf16(*(const LAS bf16x8_t*)(im + MI_K + ro + 32), vt1, Cacc, 0, 0, 0); \
        ml_stage_load(X, p, (((n_) + 2 < NCH) ? (n_) + 2 : (n_)) * 4 + h, tid, offV); \
        { v2u w; w.x = pk2(Cacc[0], Cacc[1]); w.y = pk2(Cacc[2], Cacc[3]); *(LAS v2u*)(CT + (cur ^ 1) * 16 * 72 + c * 72 + 16 * wi + 4 * g) = w; } \
        { const size_t tb = (size_t)(n_) * 64 + 16 * wi + 4 * g; \
          if (sl < 8) { _Pragma("unroll") for (int r = 0; r < 4; ++r) HO[(tb + r) * BW + h * 128 + 16 * sl + c] = num[r]; } \
          else if (c == 0 && real) { _Pragma("unroll") for (int r = 0; r < 4; ++r) HDEN[(tb + r) * 4 + h] = num[r]; } } \
        ml_stage_write(Y, IMG + (cur ^ 1) * MI_SZ, tid); \
        LDS_BAR(); } while (0)
    for (int n = 0; n < NCH; n += 2) { ML_STEP2(A, B, n); ML_STEP2(B, A, n + 1); }
#undef ML_STEP2
}

__device__ __forceinline__ void mixer_gmlp_item(const Params& p, int l, LAS unsigned char* lds, int item, int tid, int wave, int lane) {
    const int chunk = item >> 2, g = item & 3; const size_t tok0 = (size_t)chunk * 128;
    const bf16* Z = (const bf16*)(p.ws + WS_Z); bf16* BR1 = (bf16*)(p.ws + WS_BR) + 1 * BW;
    const float* ng = p.in[I_GMNG] + l * BW; const float* nb = p.in[I_GMNB] + l * BW;
    const float* wsp = p.in[I_GMWS] + ((size_t)(l * 4 + g) * 128) * 128; const float* bsp = p.in[I_GMBS] + (l * 4 + g) * 128;
    LAS float* vn = (LAS float*)lds;
    for (int r = 0; r < 16; ++r) { const int tk = wave * 16 + r;
        const v4u raw = *(const v4u*)(Z + (tok0 + tk) * ZC + ZC_GMV + 8 * lane); float x[8]; unpack8(raw, x); float s = 0.f;
#pragma unroll
        for (int i = 0; i < 8; ++i) { x[i] = gelu_tanh(x[i]); s += x[i]; }
        const float mean = wave_sum(s) * (1.f / 512.f); float ss = 0.f;
#pragma unroll
        for (int i = 0; i < 8; ++i) { x[i] -= mean; ss += x[i] * x[i]; }
        const float rstd = rsqrtf(wave_sum(ss) * (1.f / 512.f) + LN_EPS);
        if ((lane >> 4) == g) { const int cl = 8 * (lane & 15);
#pragma unroll
            for (int i = 0; i < 8; ++i) vn[tk * 128 + cl + i] = x[i] * rstd * ng[8 * lane + i] + nb[8 * lane + i]; }
    }
    __syncthreads();
    const int t = tid >> 2, cq = tid & 3; float acc[32];
#pragma unroll
    for (int i = 0; i < 32; ++i) acc[i] = 0.f;
    const float* wrow = wsp + (size_t)t * 128;
    for (int s = 0; s <= t; ++s) { const float w = wrow[s]; const LAS float* row = vn + s * 128 + cq * 32;
#pragma unroll
        for (int i4 = 0; i4 < 8; ++i4) { const v4f a = *(const LAS v4f*)(row + 4 * i4); acc[4 * i4] += w * a.x; acc[4 * i4 + 1] += w * a.y; acc[4 * i4 + 2] += w * a.z; acc[4 * i4 + 3] += w * a.w; } }
    const float bias = bsp[t];
#pragma unroll
    for (int i8 = 0; i8 < 4; ++i8) { const v4u raw = *(const v4u*)(Z + (tok0 + t) * ZC + ZC_GMU + g * 128 + cq * 32 + 8 * i8); float u[8]; unpack8(raw, u); float o[8];
#pragma unroll
        for (int i = 0; i < 8; ++i) o[i] = gelu_tanh(u[i]) * (acc[8 * i8 + i] + bias);
#if MERGE_FP8
        *(v2u*)((unsigned char*)(p.ws + WS_BR) + (tok0 + t) * BRW + 1 * BW + g * 128 + cq * 32 + 8 * i8) = (v2u){pk4_f8(o[0], o[1], o[2], o[3], BRSC), pk4_f8(o[4], o[5], o[6], o[7], BRSC)}; }
#else
        v4u w; w.x = pk2(o[0], o[1]); w.y = pk2(o[2], o[3]); w.z = pk2(o[4], o[5]); w.w = pk2(o[6], o[7]);
        *(v4u*)(BR1 + (tok0 + t) * BRW + g * 128 + cq * 32 + 8 * i8) = w; }
#endif
    __syncthreads();
}

__device__ __forceinline__ void vt_item(const Params& p, LAS unsigned char* lds, int item, int tid) {
    const int h = item & 3, n = item >> 2; const size_t t0 = (size_t)n * 64;
    const bf16* Z = (const bf16*)(p.ws + WS_Z); bf16* VT = (bf16*)(p.ws + WS_VT);
    LAS unsigned short* vs = (LAS unsigned short*)lds;
#pragma unroll
    for (int r = 0; r < 2; ++r) { const int idx = tid + 512 * r, tk = idx >> 4, c8 = idx & 15;
        *(LAS v4u*)(vs + tk * 136 + 8 * c8) = *(const v4u*)(Z + (t0 + tk) * ZC + ZC_SBV + h * 128 + 8 * c8); }
    __syncthreads();
    { const int d = tid >> 2, jq = tid & 3; unsigned w[8];
#pragma unroll
      for (int x = 0; x < 8; ++x) w[x] = (unsigned)vs[(16 * jq + 2 * x) * 136 + d] | ((unsigned)vs[(16 * jq + 2 * x + 1) * 136 + d] << 16);
      bf16* dst = VT + ((size_t)h * 128 + d) * T + t0 + 16 * jq;
      *(v4u*)dst = (v4u){w[0], w[1], w[2], w[3]}; *(v4u*)(dst + 8) = (v4u){w[4], w[5], w[6], w[7]}; }
    __syncthreads();
}
constexpr int KTP = 136, VTP = 72;
__device__ __forceinline__ void sb_unit(const Params& p, LAS unsigned char* lds, int unit, int tid, int wave, int lane) {
    const int h = unit >> 6, q0 = (unit & 63) * 128, g = lane >> 4, c = lane & 15; const int qrow = q0 + 16 * wave + c;
    const bf16* Z = (const bf16*)(p.ws + WS_Z); const bf16* VT = (const bf16*)(p.ws + WS_VT) + (size_t)h * 128 * T; bf16* BR0 = (bf16*)(p.ws + WS_BR);
    LAS unsigned short* Kt = (LAS unsigned short*)lds;
    LAS unsigned short* Vt = Kt + 2 * 64 * KTP;
    LAS int* flags = (LAS int*)(Vt + 2 * 128 * VTP);
    bf16x8_t qf[4];
#pragma unroll
    for (int ks = 0; ks < 4; ++ks) qf[ks] = *(const bf16x8_t*)(Z + (size_t)qrow * ZC + ZC_SBQ + h * 128 + 32 * ks + 8 * g);
    pg8::f32x4 acc[8];
#pragma unroll
    for (int dt = 0; dt < 8; ++dt) acc[dt] = (pg8::f32x4){0.f, 0.f, 0.f, 0.f};
    float racc = 0.f;
    v4u kr[2], vr[2];
    const int jt = (q0 >> 6) + 1;
#define SB_GLOAD(j_) do { _Pragma("unroll") for (int r = 0; r < 2; ++r) { const int idx = tid + 512 * r; \
        kr[r] = *(const v4u*)(Z + (size_t)(64 * (j_) + (idx >> 4)) * ZC + ZC_SBK + h * 128 + 8 * (idx & 15)); \
        vr[r] = *(const v4u*)(VT + (size_t)(idx >> 3) * T + 64 * (j_) + 8 * (idx & 7)); } } while (0)
#define SB_LWRITE(b_) do { _Pragma("unroll") for (int r = 0; r < 2; ++r) { const int idx = tid + 512 * r; \
        *(LAS v4u*)(Kt + (b_) * 64 * KTP + (idx >> 4) * KTP + 8 * (idx & 15)) = kr[r]; *(LAS v4u*)(Vt + (b_) * 128 * VTP + (idx >> 3) * VTP + 8 * (idx & 7)) = vr[r]; } } while (0)
    LDS_BAR();
    SB_GLOAD(jt); SB_LWRITE(0);
    LDS_BAR();
    for (int j = jt, it = 0; j >= 0; --j, ++it) {
        const int cur = it & 1;
        SB_GLOAD(j > 0 ? j - 1 : 0);
        const bool wdone = __all(racc > 104.f);
        if (64 * j < q0 + 16 * wave + 15 && !wdone) {
            const LAS unsigned short* Kc = Kt + cur * 64 * KTP; const LAS unsigned short* Vc = Vt + cur * 128 * VTP;
            pg8::f32x4 z[4];
#pragma unroll
            for (int s = 0; s < 4; ++s) { z[s] = (pg8::f32x4){0.f, 0.f, 0.f, 0.f};
#pragma unroll
                for (int ks = 0; ks < 4; ++ks) z[s] = __builtin_amdgcn_mfma_f32_16x16x32_bf16(*(const LAS bf16x8_t*)(Kc + (16 * s + c) * KTP + 32 * ks + 8 * g), qf[ks], z[s], 0, 0, 0); }
            float sp[4][4], t[4], xs[4]; bool mk[4][4];
#pragma unroll
            for (int s = 0; s < 4; ++s) { t[s] = 0.f;
#pragma unroll
                for (int r = 0; r < 4; ++r) { const int key = 64 * j + 16 * s + 4 * g + r; mk[s][r] = key < qrow; const float zz = z[s][r] * 0.08838834764831845f; z[s][r] = zz;
                    sp[s][r] = mk[s][r] ? softplusf_(zz) : 0.f; t[s] += sp[s][r]; } }
            float grand = 0.f, higher[4];
#pragma unroll
            for (int s = 3; s >= 0; --s) { float x = t[s]; float y = __shfl(x, lane + 16); x += (g < 3) ? y : 0.f; y = __shfl(x, lane + 32); x += (g < 2) ? y : 0.f;
                xs[s] = x - t[s];
                const float tot = __shfl(x, c); higher[s] = grand; grand += tot; }
            bf16x8_t pf[2];
#pragma unroll
            for (int s = 0; s < 4; ++s) { float a[4]; float e = 0.f;
#pragma unroll
                for (int r = 3; r >= 0; --r) { const float la = z[s][r] - sp[s][r] - (racc + higher[s] + xs[s] + e); a[r] = mk[s][r] ? __expf(la) : 0.f; e += sp[s][r]; }
                const unsigned w0 = pk2(a[0], a[1]), w1 = pk2(a[2], a[3]);
                if ((s & 1) == 0) { pf[s >> 1][0] = (short)(w0 & 0xffff); pf[s >> 1][1] = (short)(w0 >> 16); pf[s >> 1][2] = (short)(w1 & 0xffff); pf[s >> 1][3] = (short)(w1 >> 16); }
                else              { pf[s >> 1][4] = (short)(w0 & 0xffff); pf[s >> 1][5] = (short)(w0 >> 16); pf[s >> 1][6] = (short)(w1 & 0xffff); pf[s >> 1][7] = (short)(w1 >> 16); } }
            racc += grand;
#pragma unroll
            for (int dt = 0; dt < 8; ++dt)
#pragma unroll
                for (int k2 = 0; k2 < 2; ++k2) { const v2u lo = *(const LAS v2u*)(Vc + (16 * dt + c) * VTP + 32 * k2 + 4 * g), hi = *(const LAS v2u*)(Vc + (16 * dt + c) * VTP + 32 * k2 + 16 + 4 * g);
                    const v4u vv = (v4u){lo.x, lo.y, hi.x, hi.y};
                    acc[dt] = __builtin_amdgcn_mfma_f32_16x16x32_bf16(__builtin_bit_cast(bf16x8_t, vv), pf[k2], acc[dt], 0, 0, 0); }
        }
        const bool wd2 = __all(racc > 104.f);
        if (lane == 0) flags[cur * 8 + wave] = wd2 ? 1 : 0;
        SB_LWRITE(cur ^ 1);
        LDS_BAR();
        int alld = 1;
#pragma unroll
        for (int w = 0; w < 8; ++w) alld &= flags[cur * 8 + w];
        if (alld) break;
    }
#undef SB_GLOAD
#undef SB_LWRITE
#pragma unroll
#if MERGE_FP8
    for (int dt = 0; dt < 8; ++dt) *(unsigned*)((unsigned char*)BR0 + (size_t)qrow * BRW + h * 128 + 16 * dt + 4 * g) = pk4_f8(acc[dt][0], acc[dt][1], acc[dt][2], acc[dt][3], BRSC);
#else
    for (int dt = 0; dt < 8; ++dt) { v2u w; w.x = pk2(acc[dt][0], acc[dt][1]); w.y = pk2(acc[dt][2], acc[dt][3]); *(v2u*)(BR0 + (size_t)qrow * BRW + h * 128 + 16 * dt + 4 * g) = w; }
#endif
}

__device__ __forceinline__ void phase_mixers(const Params& p, int l, LAS unsigned char* lds, int wg, int G, int tid, int wave, int lane, const XcdBarrier& bar) {
#if defined(PROBE_SPLIT)
    if (wg < 16) gdn_seq2(p, lds, wg, tid, wave, lane); else if (wg < 36) ml_seq2(p, lds, wg - 16, tid, wave, lane);
    xcd_barrier(bar);
    const int w2 = wg, G2 = G;
#else
    if (wg < 16) { gdn_seq2(p, lds, wg, tid, wave, lane); return; }
    if (wg < 36) { ml_seq2(p, lds, wg - 16, tid, wave, lane); return; }
    const int w2 = wg - 36, G2 = G - 36;
#endif
    for (int it = w2; it < 256; it += G2) mixer_gmlp_item(p, l, lds, it, tid, wave, lane);
    for (int it = w2; it < 256; it += G2) sb_unit(p, lds, it, tid, wave, lane);
#if !defined(PROBE_CONV0)
    __syncthreads();
    {
        constexpr int NIT1 = (NEX * 2 * (D / 64) * (ED / 32)) + (NEX * (ED / 64) * (D / 32));
        const int nheavy = (G2 < 256 && 2 * G2 >= 256) ? 256 - G2 : 0, per_wave = NIT1 / (G2 * 8);
        const int NA = (nheavy > 0 && per_wave > 2 * CONV_SKIP) ? (per_wave - CONV_SKIP) * (G2 * 8) : NIT1;
        phase_convert<1>(p, l, lds, w2 * 8 + wave, G2 * 8, wave, lane, false, 0, NA);
        if (NA < NIT1 && w2 >= nheavy) phase_convert<1>(p, l, lds, (w2 - nheavy) * 8 + wave, (G2 - nheavy) * 8, wave, lane, false, NA, NIT1); }
#endif
}

__device__ __forceinline__ void phase_post(const Params& p, int l, int gw, int NGW, int lane) {
    const bf16* Z = (const bf16*)(p.ws + WS_Z); const float* GO = (const float*)(p.ws + WS_GO); const float* HO = (const float*)(p.ws + WS_HO); const float* HDEN = (const float*)(p.ws + WS_HDEN);
    bf16* BR2 = (bf16*)(p.ws + WS_BR) + 2 * BW; bf16* BR3 = (bf16*)(p.ws + WS_BR) + 3 * BW;
    const float* gng = p.in[I_GDNNG] + l * 128; const float* mng = p.in[I_MLNG] + l * BW;
    for (int t = gw; t < T; t += NGW) {
        {   const v4f a0 = *(const v4f*)(GO + (size_t)t * BW + 8 * lane), a1 = *(const v4f*)(GO + (size_t)t * BW + 8 * lane + 4); float o[8] = {a0.x, a0.y, a0.z, a0.w, a1.x, a1.y, a1.z, a1.w}; float ss = 0.f;
#pragma unroll
            for (int i = 0; i < 8; ++i) ss += o[i] * o[i];
            const float r = rsqrtf(sum16(ss) * (1.f / 128.f) + LN_EPS);
            const v4u graw = *(const v4u*)(Z + (size_t)t * ZC + ZC_GDNG + 8 * lane); float gt[8]; unpack8(graw, gt);
#pragma unroll
            for (int i = 0; i < 8; ++i) o[i] = o[i] * r * gng[(8 * lane + i) & 127] * siluf_(gt[i]);
#if MERGE_FP8
            *(v2u*)((unsigned char*)(p.ws + WS_BR) + (size_t)t * BRW + 2 * BW + 8 * lane) = (v2u){pk4_f8(o[0], o[1], o[2], o[3], BRSC), pk4_f8(o[4], o[5], o[6], o[7], BRSC)}; }
#else
            v4u w; w.x = pk2(o[0], o[1]); w.y = pk2(o[2], o[3]); w.z = pk2(o[4], o[5]); w.w = pk2(o[6], o[7]); *(v4u*)(BR2 + (size_t)t * BRW + 8 * lane) = w; }
#endif
        {   const v4f a0 = *(const v4f*)(HO + (size_t)t * BW + 8 * lane), a1 = *(const v4f*)(HO + (size_t)t * BW + 8 * lane + 4); float o[8] = {a0.x, a0.y, a0.z, a0.w, a1.x, a1.y, a1.z, a1.w}; float ss = 0.f;
            const float dn = __builtin_amdgcn_rcpf(fmaxf(fabsf(HDEN[(size_t)t * 4 + (lane >> 4)]), 1.f));
#pragma unroll
            for (int i = 0; i < 8; ++i) { o[i] *= dn; ss += o[i] * o[i]; }
            const float r = rsqrtf(sum16(ss) * (1.f / 128.f) + LN_EPS);
            const v4u graw = *(const v4u*)(Z + (size_t)t * ZC + ZC_MLO + 8 * lane); float gt[8]; unpack8(graw, gt);
#pragma unroll
            for (int i = 0; i < 8; ++i) o[i] = o[i] * r * mng[8 * lane + i] * sigmoidf_(gt[i]);
#if MERGE_FP8
            *(v2u*)((unsigned char*)(p.ws + WS_BR) + (size_t)t * BRW + 3 * BW + 8 * lane) = (v2u){pk4_f8(o[0], o[1], o[2], o[3], BRSC), pk4_f8(o[4], o[5], o[6], o[7], BRSC)}; }
#else
            v4u w; w.x = pk2(o[0], o[1]); w.y = pk2(o[2], o[3]); w.z = pk2(o[4], o[5]); w.w = pk2(o[6], o[7]); *(v4u*)(BR3 + (size_t)t * BRW + 8 * lane) = w; }
#endif
    }
}

__device__ __forceinline__ void ln_row(const float* yrow, const float* g, const float* b, int lane, v4f (&v)[8]) {
    const v4f* yr = (const v4f*)yrow + lane; float s = 0.f;
#pragma unroll
    for (int j = 0; j < 8; ++j) { v[j] = yr[64 * j]; s += (v[j].x + v[j].y) + (v[j].z + v[j].w); }
    const float mean = wave_sum(s) * (1.f / D); float s2 = 0.f;
#pragma unroll
    for (int j = 0; j < 8; ++j) { v[j] = v[j] - mean; s2 += (v[j].x * v[j].x + v[j].y * v[j].y) + (v[j].z * v[j].z + v[j].w * v[j].w); }
    const float rstd = rsqrtf(wave_sum(s2) * (1.f / D) + LN_EPS);
#pragma unroll
    for (int j = 0; j < 8; ++j) { const v4f gg = ((const v4f*)g)[lane + 64 * j], bb = ((const v4f*)b)[lane + 64 * j]; v[j] = v[j] * rstd * gg + bb; }
}
constexpr int RT_XP = 2052;
constexpr int RT_TAB = 131072 + 1024;
__device__ __forceinline__ void phase_ln1_router(const Params& p, int l, LAS unsigned char* lds, int wg, int G, int wave, int lane, int cnt_shift = 0) {
    const bf16* Y = (const bf16*)(p.ws + WS_Y); bf16* X1 = (bf16*)(p.ws + WS_X1); bf16* X1B = (bf16*)(p.ws + WS_X1B); int* LIST = (int*)(p.ws + WS_LIST); float* WL = (float*)(p.ws + WS_WL); unsigned* SLOT = (unsigned*)(p.ws + WS_SLOT);
    unsigned* cnt = (unsigned*)(p.ws + WS_CTL) + CW_CNT + l * 4096 + cnt_shift;
    const float* g1 = p.in[I_LN1G] + (size_t)l * D; const float* b1 = p.in[I_LN1B] + (size_t)l * D;
    const float* wr = p.in[I_WR] + (size_t)l * D * NE; const float rbias = p.in[I_RB][l * NE + lane];
    LAS float* xt = (LAS float*)lds;
    LAS float* part = (LAS float*)lds;
    LAS unsigned char* selm = lds + RT_TAB; LAS unsigned char* rkm = selm + 4096; LAS float* wtm = (LAS float*)(rkm + 4096); LAS unsigned* basem = (LAS unsigned*)(wtm + 4096);
    const int n_l = lane & 15, kq = lane >> 4;
    int gi = 0;
    for (int tg = wg; tg < T / 16; tg += G, ++gi) {
        {   v4f va[8], vb[8]; const size_t m0 = (size_t)tg * 16 + 2 * wave;
#pragma unroll
            for (int j = 0; j < 8; ++j) { va[j] = ld4(Y, m0 * D + 4 * lane + 256 * j, true); vb[j] = ld4(Y, (m0 + 1) * D + 4 * lane + 256 * j, true); }
            float sa = 0.f, sb = 0.f;
#pragma unroll
            for (int j = 0; j < 8; ++j) { sa += (va[j].x + va[j].y) + (va[j].z + va[j].w); sb += (vb[j].x + vb[j].y) + (vb[j].z + vb[j].w); }
            const float ma = wave_sum(sa) * (1.f / D), mb = wave_sum(sb) * (1.f / D); float qa = 0.f, qb = 0.f;
#pragma unroll
            for (int j = 0; j < 8; ++j) { va[j] = va[j] - ma; vb[j] = vb[j] - mb; qa += (va[j].x * va[j].x + va[j].y * va[j].y) + (va[j].z * va[j].z + va[j].w * va[j].w); qb += (vb[j].x * vb[j].x + vb[j].y * vb[j].y) + (vb[j].z * vb[j].z + vb[j].w * vb[j].w); }
            const float ra = rsqrtf(wave_sum(qa) * (1.f / D) + LN_EPS), rb = rsqrtf(wave_sum(qb) * (1.f / D) + LN_EPS);
#pragma unroll
            for (int j = 0; j < 8; ++j) { const v4f gg = ((const v4f*)g1)[lane + 64 * j], bb = ((const v4f*)b1)[lane + 64 * j]; va[j] = va[j] * ra * gg + bb; vb[j] = vb[j] * rb * gg + bb; }
#pragma unroll
            for (int rr = 0; rr < 2; ++rr) { const size_t m = m0 + rr; v2u* xo = (v2u*)(X1 + m * D) + lane;
#pragma unroll
                for (int j = 0; j < 8; ++j) { const v4f v = rr ? vb[j] : va[j]; xo[64 * j] = (v2u){pk2(v.x, v.y), pk2(v.z, v.w)};
#if MOE_UP_FP8
                    { unsigned w = 0; w = __builtin_amdgcn_cvt_pk_fp8_f32(v.x, v.y, w, false); w = __builtin_amdgcn_cvt_pk_fp8_f32(v.z, v.w, w, true); ((unsigned*)((unsigned char*)X1B + m * D))[lane + 64 * j] = w; }
#else
                    { v2u o; o.x = pk2(v.x, v.y); o.y = pk2(v.z, v.w); ((v2u*)(X1B + m * D))[lane + 64 * j] = o; }
#endif
                    *(LAS v4f*)(xt + (2 * wave + rr) * RT_XP + 4 * lane + 256 * j) = v; } } }
        __syncthreads();
        {   pg8::f32x4 acc[4];
#pragma unroll
            for (int i = 0; i < 4; ++i) acc[i] = (pg8::f32x4){0.f, 0.f, 0.f, 0.f};
            const float* wb = wr + (size_t)(256 * wave + 4 * kq) * NE + 4 * n_l;
            const LAS float* xa = xt + n_l * RT_XP + 256 * wave + 4 * kq;
            v4f bwa[16], bwb[16];
#define RT_LOADW(dst, sb_) do { _Pragma("unroll") for (int q = 0; q < 16; ++q) dst[q] = *(const v4f*)(wb + (size_t)(16 * (4 * (sb_) + (q >> 2)) + (q & 3)) * NE); } while (0)
#define RT_MMA(src, sb_) do { _Pragma("unroll") for (int sg = 0; sg < 4; ++sg) { const v4f a4 = *(const LAS v4f*)(xa + 16 * (4 * (sb_) + sg)); \
                _Pragma("unroll") for (int c = 0; c < 4; ++c) { const v4f b4 = src[sg * 4 + c]; const float a = c == 0 ? a4.x : c == 1 ? a4.y : c == 2 ? a4.z : a4.w; \
                    acc[0] = __builtin_amdgcn_mfma_f32_16x16x4f32(a, b4.x, acc[0], 0, 0, 0); acc[1] = __builtin_amdgcn_mfma_f32_16x16x4f32(a, b4.y, acc[1], 0, 0, 0); \
                    acc[2] = __builtin_amdgcn_mfma_f32_16x16x4f32(a, b4.z, acc[2], 0, 0, 0); acc[3] = __builtin_amdgcn_mfma_f32_16x16x4f32(a, b4.w, acc[3], 0, 0, 0); } } } while (0)
            RT_LOADW(bwa, 0);
#pragma unroll 1
            for (int h = 0; h < 2; ++h) {
                RT_LOADW(bwb, 1); RT_MMA(bwa, 0);
                if (h == 0) RT_LOADW(bwa, 2);
                RT_MMA(bwb, 1);
                wb += (size_t)128 * NE; xa += 128; asm volatile("" : "+v"(wb));
            }
#undef RT_LOADW
#undef RT_MMA
            __syncthreads();
#pragma unroll
            for (int j = 0; j < 4; ++j) *(LAS v4f*)(part + (wave * 16 + 4 * kq + j) * 64 + 4 * n_l) = (v4f){acc[0][j], acc[1][j], acc[2][j], acc[3][j]}; }
        __syncthreads();
#pragma unroll 1
        for (int rr = 0; rr < 2; ++rr) { const int lr = wave + 8 * rr; float logit = 0.f;
#pragma unroll
            for (int w = 0; w < 8; ++w) logit += part[(w * 16 + lr) * 64 + lane];
            const float s = sigmoid_div(logit), biased = s + rbias;
            const float m1 = max8(biased); const float li = (float)(lane & 7);
            const float first = min8(biased == m1 ? li : 8.f);
            const float m2 = max8(li == first ? -INFINITY : biased);
            const float gs = m1 + m2; const int myg = lane >> 3; int grank = 0;
#pragma unroll
            for (int g2 = 0; g2 < 8; ++g2) { const float o = __builtin_bit_cast(float, __builtin_amdgcn_readlane(__builtin_bit_cast(int, gs), g2 * 8)); grank += (o > gs || (o == gs && g2 < myg)) ? 1 : 0; }
            const float masked = grank < 4 ? biased : -INFINITY; int rank = 0;
#pragma unroll
            for (int e2 = 0; e2 < 64; ++e2) { const float o = __builtin_bit_cast(float, __builtin_amdgcn_readlane(__builtin_bit_cast(int, masked), e2)); rank += (o > masked || (o == masked && e2 < lane)) ? 1 : 0; }
            const float wsel = rank < 6 ? s : 0.f; const float tot = wave_sum(wsel);
            const int ri = gi * 16 + lr;
            selm[ri * 64 + lane] = (rank < 6) ? 1 : 0; rkm[ri * 64 + lane] = (unsigned char)rank; wtm[ri * 64 + lane] = wsel / tot * 2.5f; }
        __syncthreads();
    }
    const int nrows = gi * 16;
    if (wave == 0) { unsigned n = 0;
        for (int r = 0; r < nrows; ++r) n += selm[r * 64 + lane];
        unsigned base = 0; if (n && !(PROBE_NOATOM && cnt_shift)) base = __hip_atomic_fetch_add(cnt + 64 * lane, n, __ATOMIC_RELAXED, __HIP_MEMORY_SCOPE_AGENT);
        basem[lane] = base; }
    __syncthreads();
    for (int ri = wave; ri < nrows; ri += 8) { unsigned pos = basem[lane];
        for (int r = 0; r < ri; ++r) pos += selm[r * 64 + lane];
        if (selm[ri * 64 + lane]) { const size_t m = (size_t)(wg + (ri >> 4) * G) * 16 + (ri & 15); const int rk = rkm[ri * 64 + lane];
            LIST[lane * T + pos] = (int)m; WL[lane * T + pos] = wtm[ri * 64 + lane]; SLOT[m * 8 + rk] = ((unsigned)lane << 16) | pos; } }
    __syncthreads();
}
__device__ __forceinline__ void phase_combine_ln2(const Params& p, int l, void* dst, bool dbf, int gw, int NGW, int lane) {
    const bf16* X1 = (const bf16*)(p.ws + WS_X1); const bf16* YE = (const bf16*)(p.ws + WS_YEXP); const unsigned* SLOT = (const unsigned*)(p.ws + WS_SLOT);
    const unsigned* cnt = (const unsigned*)(p.ws + WS_CTL) + CW_CNT + l * 4096;
    const float* g2 = p.in[I_LN2G] + (size_t)l * D; const float* b2 = p.in[I_LN2B] + (size_t)l * D;
    const int tiles = ((int)cnt[64 * lane] + 255) >> 8; const float incl = wave_scan_incl((float)tiles);
    const int toff = (int)incl - tiles;
    const int tsh = __builtin_amdgcn_readlane((int)incl, 63);
    for (int m = gw; m < T; m += NGW) {
        v4f v[8];
#pragma unroll
        for (int j = 0; j < 8; ++j) v[j] = ld4(X1, (size_t)m * D + 4 * lane + 256 * j, true) * ALPHA;
#pragma unroll
        for (int k = 0; k < 7; ++k) { size_t row;
            if (k == 0) row = (size_t)tsh * 256 + m;
            else { const unsigned s = __builtin_amdgcn_readfirstlane(SLOT[(size_t)m * 8 + (k - 1)]); const int e = (int)(s >> 16); row = (size_t)__builtin_amdgcn_readlane(toff, e) * 256 + (s & 0xffffu); }
            const v2u* yr = (const v2u*)(YE + row * D) + lane;
#pragma unroll
            for (int j = 0; j < 8; ++j) { const v2u y = yr[64 * j]; v[j].x += bflo(y.x); v[j].y += bfhi(y.x); v[j].z += bflo(y.y); v[j].w += bfhi(y.y); } }
        float s = 0.f;
#pragma unroll
        for (int j = 0; j < 8; ++j) s += (v[j].x + v[j].y) + (v[j].z + v[j].w);
        const float mean = wave_sum(s) * (1.f / D); float s2 = 0.f;
#pragma unroll
        for (int j = 0; j < 8; ++j) { v[j] = v[j] - mean; s2 += (v[j].x * v[j].x + v[j].y * v[j].y) + (v[j].z * v[j].z + v[j].w * v[j].w); }
        const float rstd = rsqrtf(wave_sum(s2) * (1.f / D) + LN_EPS);
#pragma unroll
        for (int j = 0; j < 8; ++j) { const v4f gg = ((const v4f*)g2)[lane + 64 * j], bb = ((const v4f*)b2)[lane + 64 * j]; const v4f o = v[j] * rstd * gg + bb;
            if (dbf) ((v2u*)((bf16*)dst + (size_t)m * D))[lane + 64 * j] = (v2u){pk2(o.x, o.y), pk2(o.z, o.w)};
            else ((v4f*)((float*)dst + (size_t)m * D))[lane + 64 * j] = o; }
    }
}

constexpr int NPH = 11;
template <class S> struct DupOrder {
    S s; int n;
    __device__ __forceinline__ bool next(int i, Unit& u) const { return s.next(i >= n ? i - n : i, u); }
    __device__ __forceinline__ int row_token(int i, int r) const { return s.row_token(i >= n ? i - n : i, r); }
    __device__ __forceinline__ void a_ready(const Unit& u) const { s.a_ready(u); }
    __device__ __forceinline__ void done(const Unit& u) const { s.done(u); }
};
template <class S> __device__ __forceinline__ int count_units(const S& s) { Unit u; int n = 0; while (n < 64 && s.next(n, u)) ++n; return n; }
#define ORDER_T(k, T) typename std::conditional<PROBE_DUP == (k), DupOrder<T>, T>::type
template <class S> __device__ __forceinline__ DupOrder<S> make_order(const S& s, std::true_type) { DupOrder<S> d{s, count_units(s)}; d.n = count_units(s); return d; }
template <class S> __device__ __forceinline__ S make_order(const S& s, std::false_type) { return s; }
#define MAKE_ORDER(k, s) make_order(s, std::integral_constant<bool, PROBE_DUP == (k)>())
template <int l>
__device__ __forceinline__ void run_layer(const Params& p, LAS unsigned char* lds, const XcdBarrier& bar, int tid, int lane, int wave, int G, int wg, int gw, int NGW) {
    unsigned char* ws = p.ws;
    {
        const void* xin = (l == 0) ? (const void*)p.in[I_X] : (const void*)(ws + WS_XCUR);
        void* xout = (l == NL - 1) ? (void*)p.out : (void*)(ws + WS_XCUR);
#ifndef PROBE_DUP
#define PROBE_DUP (-1)
#endif
#define IS_GEMM_PH(k) ((k) == 1 || (k) == 5 || (k) == 6 || (k) == 8 || (k) == 9)
#define REP(k) _Pragma("nounroll") for (int _r = 0; _r < ((PROBE_DUP == (k) && !IS_GEMM_PH(k)) ? 2 + (p.ph_lo >> 20) : 1); ++_r)
#ifndef PH_MASK
#define PH_MASK 0x7ff
#endif
#define RUN(k) (((PH_MASK >> (k)) & 1) && p.ph_lo <= l * NPH + (k) && l * NPH + (k) < p.ph_hi)
#define SEAM(k) do { if (l * NPH + (k) + 1 < p.ph_hi) xcd_barrier(bar); } while (0)
        if (RUN(0)) { REP(0) { phase_convert<0>(p, l, lds, gw, NGW, wave, lane);
#if defined(PROBE_CONV0)
            phase_convert<1>(p, l, lds, gw, NGW, wave, lane);
#endif
 phase_xprep(p, l, xin, l > 0, lds, gw, NGW, tid, lane); } SEAM(0); }
        if (RUN(1)) { REP(1) { pg8::Gemm g{(const bf16*)(ws + WS_XB), (const bf16*)(ws + WS_WIN), T, ZC, D / 2, D / 2, D / 2}; pg8::StaticOrder S; S.init(T, ZC, G, wg);
            pg8::EpiBf16<0> E{(bf16*)(ws + WS_Z), ZC, nullptr, 0, 0, 1.f / 64.f};
            auto S2 = MAKE_ORDER(1, S); pg8::gemm_phase<pg8::EpiBf16<0>, ORDER_T(1, pg8::StaticOrder), true, true, true>(lds, g, S2, E); } SEAM(1); }
        if (RUN(2)) { REP(2) { for (int it = wg; it < 1536; it += G) { if (it < 512) gdn_pre_item(p, l, lds, it, tid, wave, lane); else if (it < 1024) ml_pre_item(p, l, lds, it - 512, tid, wave, lane); else vt_item(p, lds, it - 1024, tid); } } SEAM(2); }
        if (RUN(3)) { REP(3) { phase_mixers(p, l, lds, wg, G, tid, wave, lane, bar); } SEAM(3); }
        if (RUN(4)) { REP(4) { phase_post(p, l, gw, NGW, lane); } SEAM(4); }
        if (RUN(5)) { REP(5) { constexpr int KM = MERGE_FP8 ? BRW / 2 : BRW; pg8::Gemm g{(const bf16*)(ws + WS_BR), (const bf16*)(ws + WS_WBR), T, D, KM, KM, KM}; pg8::StaticOrder S; S.init(T, D, G, wg);
            EpiMergeH E{(const bf16*)(ws + WS_Z), (bf16*)(ws + WS_MSUM)};
            auto S2 = MAKE_ORDER(5, S); pg8::gemm_phase<EpiMergeH, ORDER_T(5, pg8::StaticOrder), true, true, MERGE_FP8 != 0>(lds, g, S2, E); } SEAM(5); }
        if (RUN(6)) { REP(6) { pg8::Gemm g{(const bf16*)(ws + WS_MSUM), (const bf16*)(ws + WS_WOUT), T, D, D / 2, D / 2, D / 2}; pg8::StaticOrder S; S.init(T, D, G, wg);
            EpiResid E{xin, (bf16*)(ws + WS_Y), 1.f / 64.f, l > 0};
            auto S2 = MAKE_ORDER(6, S); pg8::gemm_phase<EpiResid, ORDER_T(6, pg8::StaticOrder), true, true, true>(lds, g, S2, E); } SEAM(6); }
        if (RUN(7)) { REP(7) { phase_ln1_router(p, l, lds, wg, G, wave, lane, (PROBE_DUP == 7 && _r == 0) ? 16384 : 0); } SEAM(7); }
        if (RUN(8)) { REP(8) { const unsigned* cnt = (const unsigned*)(ws + WS_CTL) + CW_CNT + l * 4096; MoeTab M(lds); moe_tables(M, cnt, tid, lane, wave);
            UpOrder S{M, 0}; S.n = up_order_build(M, (const int*)(ws + WS_LIST), (const float*)(ws + WS_WL), wg, G, tid);
            constexpr int KU = MOE_UP_FP8 ? D / 2 : D;
            pg8::Gemm g{(const bf16*)(ws + WS_X1B), (const bf16*)(ws + WS_WUP), T, NEX * 1024, KU, KU, KU};
            EpiGluSparse E{(LAS const float*)M.wt, (bf16*)(ws + WS_HB)};
            auto S2 = MAKE_ORDER(8, S); pg8::gemm_phase_gather<EpiGluSparse, ORDER_T(8, UpOrder), MOE_UP_FP8 != 0>(lds, g, S2, E); } SEAM(8); }
        if (RUN(9)) { REP(9) { const unsigned* cnt = (const unsigned*)(ws + WS_CTL) + CW_CNT + l * 4096; MoeTab M(lds); moe_tables(M, cnt, tid, lane, wave);
            DownOrder S{M, G, wg, 8 * M.t[65]};
            constexpr int KD = MOE_DN_FP8 ? ED / 2 : ED;
            pg8::Gemm g{(const bf16*)(ws + WS_HB), (const bf16*)(ws + WS_WDN), HROWS, NEX * D, KD, KD, KD};
            EpiYexp E{(bf16*)(ws + WS_YEXP)};
            auto S2 = MAKE_ORDER(9, S); pg8::gemm_phase<EpiYexp, ORDER_T(9, DownOrder), true, true, MOE_DN_FP8 != 0>(lds, g, S2, E); } SEAM(9); }
        if (RUN(10)) { REP(10) { phase_combine_ln2(p, l, xout, l != NL - 1, gw, NGW, lane); } SEAM(10); }
#undef RUN
#undef SEAM
    }
}
__global__ void __launch_bounds__(512, 2) fwd_kernel(Params p) {
    extern __shared__ __attribute__((aligned(16))) unsigned char lds_raw[];
    LAS unsigned char* lds = (LAS unsigned char*)lds_raw;
    const int tid = threadIdx.x, lane = tid & 63, wave = __builtin_amdgcn_readfirstlane(tid >> 6);
    const int G = gridDim.x, wg = blockIdx.x, gw = wg * 8 + wave, NGW = G * 8;
    volatile LAS unsigned* MISC = (volatile LAS unsigned*)(lds + MISC_OFF);
    if (tid < 32) MISC[tid] = 0u;
    __syncthreads();
    unsigned* ctl = (unsigned*)(p.ws + WS_CTL);
    const bool multi = (p.ph_hi - p.ph_lo) > 1;
    XcdBarrier bar; bar.bar = ctl + CW_BAR; bar.x = 0; bar.st = nullptr;
    if (multi) bar = xcd_barrier_post(ctl + CW_BAR, MISC + 8);
    run_layer<0>(p, lds, bar, tid, lane, wave, G, wg, gw, NGW);
    run_layer<1>(p, lds, bar, tid, lane, wave, G, wg, gw, NGW);
}

#ifndef MK_MULTI_LAUNCH
#define MK_MULTI_LAUNCH 0
#endif
extern "C" void kernel_launch(void* const* d_in, const int* in_sizes, int n_in, void* d_out, int out_size, void* d_ws, size_t ws_size, hipStream_t stream) {
    static int grid = 0;
    if (grid == 0) {
        if (n_in != 27 || out_size != T * D || ws_size < WS_END) { fprintf(stderr, "kernel_launch: unexpected shapes (n_in %d out %d ws %zu need %zu)\n", n_in, out_size, ws_size, (size_t)WS_END); grid = -1; return; }
        int dev = 0, cus = 0, per_cu = 0;
        if (hipGetDevice(&dev) != hipSuccess || hipDeviceGetAttribute(&cus, hipDeviceAttributeMultiprocessorCount, dev) != hipSuccess) { grid = -1; return; }
        if (hipFuncSetAttribute((const void*)fwd_kernel, hipFuncAttributeMaxDynamicSharedMemorySize, LDS_BYTES) != hipSuccess) { fprintf(stderr, "kernel_launch: hipFuncSetAttribute failed\n"); grid = -1; return; }
        if (hipOccupancyMaxActiveBlocksPerMultiprocessor(&per_cu, (const void*)fwd_kernel, 512, LDS_BYTES) != hipSuccess || per_cu < 1) { fprintf(stderr, "kernel_launch: occupancy query says %d\n", per_cu); }
        (void)hipGetLastError();
        grid = cus;
    }
    if (grid < 0) return;
    (void)hipMemsetAsync((char*)d_ws + WS_CTL, 0, CTL_ZERO_BYTES, stream);
    Params p{};
    for (int i = 0; i < 27; ++i) p.in[i] = (const float*)d_in[i];
    p.out = (float*)d_out; p.ws = (unsigned char*)d_ws;
#if MK_MULTI_LAUNCH
    for (int ph = 0; ph < NL * NPH; ++ph) { p.ph_lo = ph; p.ph_hi = ph + 1; hipLaunchKernelGGL(fwd_kernel, dim3(grid), dim3(512), LDS_BYTES, stream, p); }
#else
    p.ph_lo = 0; p.ph_hi = NL * NPH; hipLaunchKernelGGL(fwd_kernel, dim3(grid), dim3(512), LDS_BYTES, stream, p);
#endif
}
```

```cpp
#include <hip/hip_runtime.h>
#include <cstdio>
#include <cstdint>
#include <type_traits>
namespace pg8 {
#define PG8_LAS __attribute__((address_space(3)))
typedef unsigned short bf16_t;
typedef short bf16x8 __attribute__((ext_vector_type(8)));
typedef float f32x4 __attribute__((ext_vector_type(4)));
typedef unsigned u32x4 __attribute__((ext_vector_type(4)));
constexpr int BM = 256, BK = 64, HALF = 128, HTB = HALF * BK * 2  , STAGE_BYTES = 8 * HTB, NXCD = 8, WGM = 8;

__host__ __device__ __forceinline__ int lds_byte(int r, int c) { const int st = (r >> 4) * 2 + (c >> 5), rr = r & 15, cc = c & 31, ob = rr * 64 + cc * 2; return st * 1024 + (ob ^ (((ob >> 9) & 1) << 5)); }
__host__ __device__ __forceinline__ void stage_rc(int b, int& R, int& C) { const int st = b / 1024, sb = b % 1024, swz = sb ^ (((sb >> 9) & 1) << 5); R = (st >> 1) * 16 + swz / 64; C = (st & 1) * 32 + (swz % 64) / 2; }
__host__ __device__ __forceinline__ int perm32(int rho) { const int n = rho >> 4, i = rho & 15; return 8 * (i >> 2) + 4 * n + (i & 3); }

struct Unit { int pm, pn, aux; };
struct Gemm { const bf16_t* A; const bf16_t* Bt; int M, N, K, lda, ldb; };

struct StaticOrder {
    int nM, nN, nwg, G, c;
    __host__ __device__ void init(int M, int N, int G_, int c_) { nM = M / BM; nN = N / BM; nwg = nM * nN; G = G_; c = c_; }
    __host__ __device__ bool next(int i, Unit& u) const {
        const long L = (long)i * G + c; if (L >= nwg) return false;
        int wgid = (int)L; { const int q = nwg / NXCD, r = nwg % NXCD, xcd = wgid % NXCD, off = wgid / NXCD; wgid = (xcd < r ? xcd * (q + 1) : r * (q + 1) + (xcd - r) * q) + off; }
        const int nig = WGM * nN, gid = wgid / nig, fm = gid * WGM, gsz = (nM - fm) < WGM ? (nM - fm) : WGM;
        u.pm = fm + ((wgid % nig) % gsz); u.pn = (wgid % nig) / gsz; return true;
    }
    __device__ __forceinline__ void a_ready(const Unit&) const {}
    __device__ __forceinline__ void done(const Unit&) const {}
};

__device__ __forceinline__ unsigned cvt_pk_bf16(float lo, float hi) { unsigned r; asm volatile("v_cvt_pk_bf16_f32 %0, %1, %2" : "=v"(r) : "v"(lo), "v"(hi)); return r; }
typedef float f32x2 __attribute__((ext_vector_type(2)));
__device__ __forceinline__ f32x2 gelu_pk(f32x2 v) {
    const f32x2 av = __builtin_elementwise_abs(v), d = av * 0.2316418882f + 1.0f;
    f32x2 t; t.x = __builtin_amdgcn_rcpf(d.x); t.y = __builtin_amdgcn_rcpf(d.y);
    f32x2 q = t * 0.5307027145f + (-0.7265760135f); q = q * t + 0.7107068705f; q = q * t + (-0.142248368f); q = q * t + 0.127414796f; q = q * t;
    const f32x2 s = (v * v) * (-0.72134752044f);
    f32x2 e; e.x = __builtin_amdgcn_exp2f(s.x); e.y = __builtin_amdgcn_exp2f(s.y);
    const f32x2 m = v * (q * e), r = v - m;
    f32x2 o; o.x = v.x < 0.f ? m.x : r.x; o.y = v.y < 0.f ? m.y : r.y; return o;
}

template <int ACT  > struct EpiBf16 {
    static constexpr bool PERM = true, AFTER_DRAIN = false; static constexpr int MID = 0; static_assert(ACT == 0 || ACT == 1, "EpiBf16: ACT is 0 (none) or 1 (gelu_pk)");
    bf16_t* O; int ldc; const float* bias; int split_cols; size_t split_stride; float scale0;
    __device__ __forceinline__ void operator()(const f32x4 (&acc)[2][2][4][2], const Unit& u, int wr, int wc, int fr, int fq) const {
        const int row0 = u.pm * BM + wr * 64 + fr; int colt = u.pn * BM; bf16_t* base = O;
        float sc = scale0; if (split_cols) { const int t = colt / split_cols; base += (size_t)t * split_stride; colt -= t * split_cols; if (t != 0) sc = 1.f; }
        const int col0 = colt + wc * 32 + 8 * fq, bcol0 = u.pn * BM + wc * 32 + 8 * fq;
        f32x4 bv[2][2];
#pragma unroll
        for (int bj = 0; bj < 2; ++bj)
#pragma unroll
            for (int n = 0; n < 2; ++n) bv[bj][n] = bias ? *(const f32x4*)(bias + bcol0 + bj * HALF + 4 * n) : (f32x4){0.f, 0.f, 0.f, 0.f};
#pragma unroll
        for (int ai = 0; ai < 2; ++ai)
#pragma unroll
            for (int m = 0; m < 4; ++m) { bf16_t* rowp = base + (size_t)(row0 + ai * HALF + m * 16) * ldc + col0;
#pragma unroll
                for (int bj = 0; bj < 2; ++bj) { f32x4 v0 = acc[ai][bj][m][0] + bv[bj][0], v1 = acc[ai][bj][m][1] + bv[bj][1];
                    if (ACT == 1) { f32x2 a = gelu_pk((f32x2){v0[0], v0[1]}), b = gelu_pk((f32x2){v0[2], v0[3]}), c = gelu_pk((f32x2){v1[0], v1[1]}), d = gelu_pk((f32x2){v1[2], v1[3]});
                        v0 = (f32x4){a.x, a.y, b.x, b.y}; v1 = (f32x4){c.x, c.y, d.x, d.y}; }
                    v0 = v0 * sc; v1 = v1 * sc; u32x4 w; w.x = cvt_pk_bf16(v0[0], v0[1]); w.y = cvt_pk_bf16(v0[2], v0[3]); w.z = cvt_pk_bf16(v1[0], v1[1]); w.w = cvt_pk_bf16(v1[2], v1[3]);
                    *(u32x4*)(rowp + bj * HALF) = w; } }
    }
};

typedef int i32x8 __attribute__((ext_vector_type(8)));
__device__ __forceinline__ i32x8 cat8(const bf16x8 a, const bf16x8 b) { typedef int i32x4 __attribute__((ext_vector_type(4))); const i32x4 x = __builtin_bit_cast(i32x4, a), y = __builtin_bit_cast(i32x4, b); return (i32x8){x[0], x[1], x[2], x[3], y[0], y[1], y[2], y[3]}; }
__device__ __forceinline__ bf16x8 lo8(const i32x8 v) { typedef int i32x4 __attribute__((ext_vector_type(4))); return __builtin_bit_cast(bf16x8, __builtin_shufflevector(v, v, 0, 1, 2, 3)); }
__device__ __forceinline__ bf16x8 hi8(const i32x8 v) { typedef int i32x4 __attribute__((ext_vector_type(4))); return __builtin_bit_cast(bf16x8, __builtin_shufflevector(v, v, 4, 5, 6, 7)); }
template <class Epi, class Sched, bool ALIGN_EPI = false, bool SP2 = false, bool FP8 = false>
__device__ __forceinline__ void gemm_phase(PG8_LAS unsigned char* lds, const Gemm g, const Sched& S, const Epi& E) {
    const int tid = threadIdx.x, wid = __builtin_amdgcn_readfirstlane(tid >> 6), lane = tid & 63, wr = wid >> 2, wc = wid & 3, fr = lane & 15, fq = lane >> 4;
    const int K = g.K, nt = K / BK;
    unsigned voffA[2], voffB[2];
#pragma unroll
    for (int i = 0; i < 2; ++i) { int R, C; stage_rc(tid * 16 + i * 8192, R, C); const int Rb = Epi::PERM ? ((R & ~31) + perm32(R & 31)) : R;
        voffA[i] = (unsigned)(R * g.lda + C) * 2u; voffB[i] = (unsigned)(Rb * g.ldb + C) * 2u; }
    const size_t kstep = (size_t)(BK * 2);
    const size_t hstepA = (size_t)HALF * g.lda * 2, hstepB = (size_t)HALF * g.ldb * 2;
    const size_t tstepA = 2 * hstepA, tstepB = 2 * hstepB;
    const unsigned ldsw = (unsigned)wid * 1024u;
    const int aoff = lds_byte(wr * 64 + fr, fq * 8), boff = lds_byte(wc * 32 + fr, fq * 8);
#define PG8_SA(b, h) (((b) * 2 + (h)) * HTB)
#define PG8_SB(b, h) ((4 + (b) * 2 + (h)) * HTB)
#define PG8_STAGE(bufoff, gbase, voff) do { _Pragma("unroll") for (int _i = 0; _i < 2; ++_i) \
        __builtin_amdgcn_global_load_lds((const unsigned*)((const char*)(gbase) + (voff)[_i]), (PG8_LAS unsigned*)(lds + (bufoff) + ldsw + _i * 8192), 16, 0, 0); } while (0)
#define PG8_LDA(dst, b, h) do { _Pragma("unroll") for (int m = 0; m < 4; ++m) { if constexpr (FP8) dst##8[m] = cat8(*(const PG8_LAS bf16x8*)(lds + PG8_SA(b, h) + aoff + m * 2048), *(const PG8_LAS bf16x8*)(lds + PG8_SA(b, h) + aoff + m * 2048 + 1024)); \
        else { _Pragma("unroll") for (int k = 0; k < 2; ++k) dst[m][k] = *(const PG8_LAS bf16x8*)(lds + PG8_SA(b, h) + aoff + m * 2048 + k * 1024); } } } while (0)
#define PG8_LDB(dst, b, h) do { _Pragma("unroll") for (int n = 0; n < 2; ++n) { if constexpr (FP8) dst##8[n] = cat8(*(const PG8_LAS bf16x8*)(lds + PG8_SB(b, h) + boff + n * 2048), *(const PG8_LAS bf16x8*)(lds + PG8_SB(b, h) + boff + n * 2048 + 1024)); \
        else { _Pragma("unroll") for (int k = 0; k < 2; ++k) dst[n][k] = *(const PG8_LAS bf16x8*)(lds + PG8_SB(b, h) + boff + n * 2048 + k * 1024); } } } while (0)
#define PG8_MMA(ai, bj, At, Bt) do { __builtin_amdgcn_s_setprio(1); _Pragma("unroll") for (int m = 0; m < 4; ++m) _Pragma("unroll") for (int n = 0; n < 2; ++n) { \
        if constexpr (FP8) asm volatile("v_mfma_scale_f32_16x16x128_f8f6f4 %0, %1, %2, %0, %3, %3 op_sel_hi:[0,0,0]" : "+v"(acc[ai][bj][m][n]) : "v"(Bt##8[n]), "v"(At##8[m]), "v"(fp8_unit_scale)); \
        else { _Pragma("unroll") for (int k = 0; k < 2; ++k) acc[ai][bj][m][n] = __builtin_amdgcn_mfma_f32_16x16x32_bf16(Bt[n][k], At[m][k], acc[ai][bj][m][n], 0, 0, 0); } } __builtin_amdgcn_s_setprio(0); } while (0)
#define PG8_WAIT_V(n) asm volatile("s_waitcnt vmcnt(" #n ")" ::: "memory")
#define PG8_WAIT_L(n) asm volatile("s_waitcnt lgkmcnt(" #n ")" ::: "memory")
#define PG8_BAR __builtin_amdgcn_s_barrier()
#define PG8_SCHED __builtin_amdgcn_sched_barrier(0)
    Unit cur, nxt; int ui = 0;
    if (!S.next(0, cur)) return;
    f32x4 acc[2][2][4][2];
#pragma unroll
    for (int a = 0; a < 2; ++a)
#pragma unroll
        for (int b = 0; b < 2; ++b)
#pragma unroll
            for (int m = 0; m < 4; ++m)
#pragma unroll
                for (int n = 0; n < 2; ++n) acc[a][b][m][n] = (f32x4){0.f, 0.f, 0.f, 0.f};
    int fp8_unit_scale = 0x7F7F7F7F; asm volatile("" : "+v"(fp8_unit_scale));
    bf16x8 At[4][2], B0[2][2], B1[2][2];
    i32x8 At8[4], B08[2], B18[2];
    const char* cA = (const char*)g.A + (size_t)cur.pm * tstepA; const char* cB = (const char*)g.Bt + (size_t)cur.pn * tstepB;
    S.a_ready(cur);
    if constexpr (SP2) {
        PG8_STAGE(PG8_SB(0, 0), cB, voffB); PG8_STAGE(PG8_SB(0, 1), cB + hstepB, voffB); PG8_STAGE(PG8_SA(0, 0), cA, voffA); PG8_STAGE(PG8_SA(0, 1), cA + hstepA, voffA);
        if (wr == 1) PG8_BAR;
        PG8_WAIT_V(2); PG8_BAR;
        PG8_STAGE(PG8_SB(1, 0), cB + kstep, voffB); PG8_STAGE(PG8_SA(1, 0), cA + kstep, voffA); PG8_STAGE(PG8_SB(1, 1), cB + hstepB + kstep, voffB);
        PG8_WAIT_V(6); PG8_BAR;
    } else {
        PG8_STAGE(PG8_SB(0, 0), cB, voffB); PG8_STAGE(PG8_SA(0, 0), cA, voffA); PG8_STAGE(PG8_SB(0, 1), cB + hstepB, voffB); PG8_STAGE(PG8_SA(0, 1), cA + hstepA, voffA);
        if (wr == 1) PG8_BAR;
        PG8_WAIT_V(4); PG8_BAR;
        PG8_STAGE(PG8_SB(1, 0), cB + kstep, voffB); PG8_STAGE(PG8_SA(1, 0), cA + kstep, voffA); PG8_STAGE(PG8_SB(1, 1), cB + hstepB + kstep, voffB);
        PG8_WAIT_V(6); PG8_BAR;
    }
    for (;;) {
        const bool has_next = S.next(ui + 1, nxt);
        const char* nA = has_next ? (const char*)g.A + (size_t)nxt.pm * tstepA : cA; const char* nB = has_next ? (const char*)g.Bt + (size_t)nxt.pn * tstepB : cB;
        for (int t = 0; t < nt; t += 2) {
            const bool last = (t == nt - 2);
            const char* a1 = cA + (size_t)(t + 1) * kstep;
            const char* a2 = last ? nA : cA + (size_t)(t + 2) * kstep; const char* b2 = last ? nB : cB + (size_t)(t + 2) * kstep;
            const char* a3 = a2 + kstep; const char* b3 = b2 + kstep;
            if (last && has_next) S.a_ready(nxt);
            if constexpr (SP2) {
            if constexpr (Epi::MID > 0) { if (t != 0 && (t % Epi::MID) == 0) { PG8_SCHED; if constexpr (FP8) asm volatile("s_nop 7\n\ts_nop 7" ::: "memory"); E.mid(acc, cur, t / Epi::MID, wr, wc, fr, fq); if constexpr (FP8) asm volatile("s_nop 7" ::: "memory"); PG8_SCHED; } }
            PG8_LDB(B0, 0, 0); PG8_LDB(B1, 0, 1); PG8_SCHED; PG8_LDA(At, 0, 0); PG8_STAGE(PG8_SA(1, 1), a1 + hstepA, voffA);
            PG8_WAIT_V(8); PG8_WAIT_L(0); PG8_BAR; PG8_MMA(0, 0, At, B0); PG8_MMA(0, 1, At, B1); PG8_BAR; PG8_SCHED;
            PG8_LDA(At, 0, 1); PG8_STAGE(PG8_SB(0, 0), b2, voffB); PG8_STAGE(PG8_SB(0, 1), b2 + hstepB, voffB); PG8_STAGE(PG8_SA(0, 0), a2, voffA);
            PG8_WAIT_V(8); PG8_WAIT_L(0); PG8_BAR; PG8_MMA(1, 0, At, B0); PG8_MMA(1, 1, At, B1); PG8_BAR; PG8_SCHED;
            PG8_LDB(B0, 1, 0); PG8_LDB(B1, 1, 1); PG8_SCHED; PG8_LDA(At, 1, 0); PG8_STAGE(PG8_SA(0, 1), a2 + hstepA, voffA);
            PG8_WAIT_V(8); PG8_WAIT_L(0); PG8_BAR; PG8_MMA(0, 0, At, B0); PG8_MMA(0, 1, At, B1); PG8_BAR; PG8_SCHED;
            PG8_LDA(At, 1, 1); PG8_STAGE(PG8_SB(1, 0), b3, voffB); PG8_STAGE(PG8_SB(1, 1), b3 + hstepB, voffB); PG8_STAGE(PG8_SA(1, 0), a3, voffA);
            PG8_WAIT_V(8); PG8_WAIT_L(0); PG8_BAR; PG8_MMA(1, 0, At, B0); PG8_MMA(1, 1, At, B1); PG8_BAR; PG8_SCHED;
            } else {
            PG8_LDB(B0, 0, 0); PG8_SCHED; PG8_LDA(At, 0, 0); PG8_STAGE(PG8_SA(1, 1), a1 + hstepA, voffA);
            PG8_WAIT_L(8); PG8_BAR; PG8_WAIT_L(0); PG8_MMA(0, 0, At, B0); PG8_BAR; PG8_SCHED;
            PG8_LDB(B1, 0, 1); PG8_STAGE(PG8_SB(0, 0), b2, voffB);
            PG8_BAR; PG8_WAIT_L(0); PG8_MMA(0, 1, At, B1); PG8_BAR;
            PG8_LDA(At, 0, 1); PG8_STAGE(PG8_SA(0, 0), a2, voffA);
            PG8_BAR; PG8_WAIT_L(0); PG8_MMA(1, 0, At, B0); PG8_BAR; PG8_SCHED;
            PG8_STAGE(PG8_SB(0, 1), b2 + hstepB, voffB);
            PG8_WAIT_V(6); PG8_BAR; PG8_MMA(1, 1, At, B1); PG8_BAR;
            PG8_LDB(B0, 1, 0); PG8_SCHED; PG8_LDA(At, 1, 0); PG8_STAGE(PG8_SA(0, 1), a2 + hstepA, voffA);
            PG8_WAIT_L(8); PG8_BAR; PG8_WAIT_L(0); PG8_MMA(0, 0, At, B0); PG8_BAR; PG8_SCHED;
            PG8_LDB(B1, 1, 1); PG8_STAGE(PG8_SB(1, 0), b3, voffB);
            PG8_BAR; PG8_WAIT_L(0); PG8_MMA(0, 1, At, B1); PG8_BAR;
            PG8_LDA(At, 1, 1); PG8_STAGE(PG8_SA(1, 0), a3, voffA);
            PG8_BAR; PG8_WAIT_L(0); PG8_MMA(1, 0, At, B0); PG8_BAR; PG8_SCHED;
            PG8_STAGE(PG8_SB(1, 1), b3 + hstepB, voffB);
            PG8_WAIT_V(6); PG8_BAR; PG8_MMA(1, 1, At, B1); PG8_BAR;
            }
        }
        if constexpr (ALIGN_EPI) { if (wr == 0) PG8_BAR; }
        if constexpr (FP8) asm volatile("s_nop 7\n\ts_nop 7" ::: "memory");
        if constexpr (!Epi::AFTER_DRAIN) { E(acc, cur, wr, wc, fr, fq); S.done(cur); }
        if (!has_next) break;
#pragma unroll
        for (int a = 0; a < 2; ++a)
#pragma unroll
            for (int b = 0; b < 2; ++b)
#pragma unroll
                for (int m = 0; m < 4; ++m)
#pragma unroll
                    for (int n = 0; n < 2; ++n) acc[a][b][m][n] = (f32x4){0.f, 0.f, 0.f, 0.f};
        cur = nxt; cA = nA; cB = nB; ++ui;
        if constexpr (ALIGN_EPI) { if (wr == 1) PG8_BAR; }
    }
    PG8_WAIT_V(0);
    if constexpr (!ALIGN_EPI) { if (wr == 0) PG8_BAR; }
    PG8_BAR;
    if constexpr (Epi::AFTER_DRAIN) { E.fused(acc, cur, wr, wc, fr, fq, lds, wid, lane); S.done(cur); }
#undef PG8_SA
#undef PG8_SB
#undef PG8_STAGE
#undef PG8_LDA
#undef PG8_LDB
#undef PG8_MMA
#undef PG8_WAIT_V
#undef PG8_WAIT_L
#undef PG8_BAR
#undef PG8_SCHED
}
template <class Epi, class Sched, bool FP8 = false>
__device__ __forceinline__ void gemm_phase_gather(PG8_LAS unsigned char* lds, const Gemm g, const Sched& S, const Epi& E) {
    const int tid = threadIdx.x, wid = __builtin_amdgcn_readfirstlane(tid >> 6), lane = tid & 63, wr = wid >> 2, wc = wid & 3, fr = lane & 15, fq = lane >> 4;
    const int K = g.K, nt = K / BK;
    unsigned voffB[2]; int RA[2], CA[2];
#pragma unroll
    for (int i = 0; i < 2; ++i) { int R, C; stage_rc(tid * 16 + i * 8192, R, C); const int Rb = Epi::PERM ? ((R & ~31) + perm32(R & 31)) : R;
        RA[i] = R; CA[i] = C; voffB[i] = (unsigned)(Rb * g.ldb + C) * 2u; }
    const size_t kstep = (size_t)(BK * 2);
    const size_t hstepB = (size_t)HALF * g.ldb * 2, tstepB = 2 * hstepB;
    const unsigned ldsw = (unsigned)wid * 1024u;
    const int aoff = lds_byte(wr * 64 + fr, fq * 8), boff = lds_byte(wc * 32 + fr, fq * 8);
#define PG8_SA(b, h) (((b) * 2 + (h)) * HTB)
#define PG8_SB(b, h) ((4 + (b) * 2 + (h)) * HTB)
#define PG8_STAGE(bufoff, gbase, voff) do { _Pragma("unroll") for (int _i = 0; _i < 2; ++_i) \
        __builtin_amdgcn_global_load_lds((const unsigned*)((const char*)(gbase) + (voff)[_i]), (PG8_LAS unsigned*)(lds + (bufoff) + ldsw + _i * 8192), 16, 0, 0); } while (0)
#define PG8_LDA(dst, b, h) do { _Pragma("unroll") for (int m = 0; m < 4; ++m) { if constexpr (FP8) dst##8[m] = cat8(*(const PG8_LAS bf16x8*)(lds + PG8_SA(b, h) + aoff + m * 2048), *(const PG8_LAS bf16x8*)(lds + PG8_SA(b, h) + aoff + m * 2048 + 1024)); \
        else { _Pragma("unroll") for (int k = 0; k < 2; ++k) dst[m][k] = *(const PG8_LAS bf16x8*)(lds + PG8_SA(b, h) + aoff + m * 2048 + k * 1024); } } } while (0)
#define PG8_LDB(dst, b, h) do { _Pragma("unroll") for (int n = 0; n < 2; ++n) { if constexpr (FP8) dst##8[n] = cat8(*(const PG8_LAS bf16x8*)(lds + PG8_SB(b, h) + boff + n * 2048), *(const PG8_LAS bf16x8*)(lds + PG8_SB(b, h) + boff + n * 2048 + 1024)); \
        else { _Pragma("unroll") for (int k = 0; k < 2; ++k) dst[n][k] = *(const PG8_LAS bf16x8*)(lds + PG8_SB(b, h) + boff + n * 2048 + k * 1024); } } } while (0)
#define PG8_MMA(ai, bj, At, Bt) do { __builtin_amdgcn_s_setprio(1); _Pragma("unroll") for (int m = 0; m < 4; ++m) _Pragma("unroll") for (int n = 0; n < 2; ++n) { \
        if constexpr (FP8) asm volatile("v_mfma_scale_f32_16x16x128_f8f6f4 %0, %1, %2, %0, %3, %3 op_sel_hi:[0,0,0]" : "+v"(acc[ai][bj][m][n]) : "v"(Bt##8[n]), "v"(At##8[m]), "v"(fp8_unit_scale)); \
        else { _Pragma("unroll") for (int k = 0; k < 2; ++k) acc[ai][bj][m][n] = __builtin_amdgcn_mfma_f32_16x16x32_bf16(Bt[n][k], At[m][k], acc[ai][bj][m][n], 0, 0, 0); } } __builtin_amdgcn_s_setprio(0); } while (0)
#define PG8_WAIT_V(n) asm volatile("s_waitcnt vmcnt(" #n ")" ::: "memory")
#define PG8_WAIT_L(n) asm volatile("s_waitcnt lgkmcnt(" #n ")" ::: "memory")
#define PG8_BAR __builtin_amdgcn_s_barrier()
#define PG8_SCHED __builtin_amdgcn_sched_barrier(0)
#define PG8_ROWS(dst, ui_) do { _Pragma("unroll") for (int _h = 0; _h < 2; ++_h) _Pragma("unroll") for (int _i = 0; _i < 2; ++_i) \
        dst[_h][_i] = (unsigned)S.row_token((ui_), _h * HALF + RA[_i]) * (unsigned)(g.lda * 2) + (unsigned)(CA[_i] * 2); } while (0)
    Unit cur, nxt; int ui = 0;
    if (!S.next(0, cur)) return;
    f32x4 acc[2][2][4][2];
#pragma unroll
    for (int a = 0; a < 2; ++a)
#pragma unroll
        for (int b = 0; b < 2; ++b)
#pragma unroll
            for (int m = 0; m < 4; ++m)
#pragma unroll
                for (int n = 0; n < 2; ++n) acc[a][b][m][n] = (f32x4){0.f, 0.f, 0.f, 0.f};
    int fp8_unit_scale = 0x7F7F7F7F; asm volatile("" : "+v"(fp8_unit_scale));
    bf16x8 At[4][2], B0[2][2], B1[2][2];
    i32x8 At8[4], B08[2], B18[2];
    unsigned offC[2][2];
    PG8_ROWS(offC, 0);
    const char* gA = (const char*)g.A;
    const char* cB = (const char*)g.Bt + (size_t)cur.pn * tstepB;
    PG8_STAGE(PG8_SB(0, 0), cB, voffB); PG8_STAGE(PG8_SB(0, 1), cB + hstepB, voffB); PG8_STAGE(PG8_SA(0, 0), gA, offC[0]); PG8_STAGE(PG8_SA(0, 1), gA, offC[1]);
    if (wr == 1) PG8_BAR;
    PG8_WAIT_V(2); PG8_BAR;
    PG8_STAGE(PG8_SB(1, 0), cB + kstep, voffB); PG8_STAGE(PG8_SA(1, 0), gA + kstep, offC[0]); PG8_STAGE(PG8_SB(1, 1), cB + hstepB + kstep, voffB);
    PG8_WAIT_V(6); PG8_BAR;
    for (;;) {
        const bool has_next = S.next(ui + 1, nxt);
        const char* nB = has_next ? (const char*)g.Bt + (size_t)nxt.pn * tstepB : cB;
        for (int t = 0; t < nt; t += 2) {
            const bool last = (t == nt - 2);
            const char* a1 = gA + (size_t)(t + 1) * kstep;
            const char* a2 = last ? gA : gA + (size_t)(t + 2) * kstep; const char* b2 = last ? nB : cB + (size_t)(t + 2) * kstep;
            const char* a3 = a2 + kstep; const char* b3 = b2 + kstep;
            PG8_LDB(B0, 0, 0); PG8_LDB(B1, 0, 1); PG8_SCHED; PG8_LDA(At, 0, 0); PG8_STAGE(PG8_SA(1, 1), a1, offC[1]);
            if (last && has_next) { PG8_ROWS(offC, ui + 1); }
            PG8_WAIT_V(8); PG8_WAIT_L(0); PG8_BAR; PG8_MMA(0, 0, At, B0); PG8_MMA(0, 1, At, B1); PG8_BAR; PG8_SCHED;
            PG8_LDA(At, 0, 1); PG8_STAGE(PG8_SB(0, 0), b2, voffB); PG8_STAGE(PG8_SB(0, 1), b2 + hstepB, voffB); PG8_STAGE(PG8_SA(0, 0), a2, offC[0]);
            PG8_WAIT_V(8); PG8_WAIT_L(0); PG8_BAR; PG8_MMA(1, 0, At, B0); PG8_MMA(1, 1, At, B1); PG8_BAR; PG8_SCHED;
            PG8_LDB(B0, 1, 0); PG8_LDB(B1, 1, 1); PG8_SCHED; PG8_LDA(At, 1, 0); PG8_STAGE(PG8_SA(0, 1), a2, offC[1]);
            PG8_WAIT_V(8); PG8_WAIT_L(0); PG8_BAR; PG8_MMA(0, 0, At, B0); PG8_MMA(0, 1, At, B1); PG8_BAR; PG8_SCHED;
            PG8_LDA(At, 1, 1); PG8_STAGE(PG8_SB(1, 0), b3, voffB); PG8_STAGE(PG8_SB(1, 1), b3 + hstepB, voffB); PG8_STAGE(PG8_SA(1, 0), a3, offC[0]);
            PG8_WAIT_V(8); PG8_WAIT_L(0); PG8_BAR; PG8_MMA(1, 0, At, B0); PG8_MMA(1, 1, At, B1); PG8_BAR; PG8_SCHED;
        }
        if (wr == 0) PG8_BAR;
        if constexpr (FP8) asm volatile("s_nop 7\n\ts_nop 7" ::: "memory");
        E(acc, cur, wr, wc, fr, fq); S.done(cur);
        if (!has_next) break;
#pragma unroll
        for (int a = 0; a < 2; ++a)
#pragma unroll
            for (int b = 0; b < 2; ++b)
#pragma unroll
                for (int m = 0; m < 4; ++m)
#pragma unroll
                    for (int n = 0; n < 2; ++n) acc[a][b][m][n] = (f32x4){0.f, 0.f, 0.f, 0.f};
        cur = nxt; cB = nB; ++ui;
        if (wr == 1) PG8_BAR;
    }
    PG8_WAIT_V(0);
    PG8_BAR;
#undef PG8_ROWS
#undef PG8_SA
#undef PG8_SB
#undef PG8_STAGE
#undef PG8_LDA
#undef PG8_LDB
#undef PG8_MMA
#undef PG8_WAIT_V
#undef PG8_WAIT_L
#undef PG8_BAR
#undef PG8_SCHED
}
}

#ifndef YEXP_FP8
#define YEXP_FP8 1
#endif
#ifndef CONV_SKIP
#define CONV_SKIP 6
#endif
#ifndef MERGE_FP8
#define MERGE_FP8 1
#endif
#ifndef MOE_DN_FP8
#define MOE_DN_FP8 1
#endif
#ifndef MOE_UP_FP8
#define MOE_UP_FP8 1
#endif
#ifndef PROBE_NOATOM
#define PROBE_NOATOM 0
#endif
constexpr int T = 8192, D = 2048, NL = 2, BW = 512, ZC = 14336, INC = 14352;
constexpr int NE = 64, NEX = 65  , ED = 512;
constexpr int BRW = 4 * BW;
constexpr int HK = NEX * ED;
constexpr float ALPHA = 1.41421356237f;
constexpr float LN_EPS = 1e-5f;
constexpr float UPSC = MOE_UP_FP8 ? (1.f / 64.f) : 1.f;
constexpr float BRSC = MERGE_FP8 ? 8.f : 1.f, MGSC = MERGE_FP8 ? (1.f / (8.f * 64.f)) : 1.f;
constexpr float YSC = 64.f;
constexpr float HSC = 8.f, DNSC = MOE_DN_FP8 ? (1.f / (HSC * 64.f)) : 1.f;
constexpr int ZC_SBQ = 0, ZC_SBK = 512, ZC_SBV = 1024, ZC_GMU = 1536, ZC_GMV = 2048, ZC_GDN = 2560, ZC_GDNG = 4096,
              ZC_MLQ = 4608, ZC_MLK = 4864, ZC_MLV = 5120, ZC_MLO = 5632, ZC_GATE = 6144;

#define GAS __attribute__((address_space(1)))
#define LAS __attribute__((address_space(3)))
typedef unsigned short bf16;
typedef unsigned v4u __attribute__((ext_vector_type(4)));
typedef unsigned v2u __attribute__((ext_vector_type(2)));
typedef float v4f __attribute__((ext_vector_type(4)));
typedef float v2f __attribute__((ext_vector_type(2)));
#define LDS_WAIT() asm volatile("s_waitcnt lgkmcnt(0)" ::: "memory")
#define LDS_BAR() do { asm volatile("s_waitcnt lgkmcnt(0)" ::: "memory"); __builtin_amdgcn_s_barrier(); asm volatile("" ::: "memory"); } while (0)

constexpr size_t MiB = 1u << 20;
constexpr size_t WS_CTL = 0, CTL_ZERO_BYTES = 1 * MiB;
constexpr size_t WS_WIN = 2 * MiB, WS_WBR = 58 * MiB, WS_WOUT = 66 * MiB, WS_WUP = 74 * MiB, WS_WDN = 334 * MiB;
constexpr size_t WS_XB = 464 * MiB, WS_SMALL = 496 * MiB, WS_EG = 497 * MiB, WS_BETA = WS_EG + 256 * 1024, WS_COMB = 498 * MiB;
constexpr size_t WS_Z = 500 * MiB, WS_GQ = 724 * MiB, WS_GK = 740 * MiB, WS_GV = 756 * MiB, WS_GO = 772 * MiB, WS_HO = 788 * MiB;
constexpr size_t WS_BR = 804 * MiB, WS_MTMP = 836 * MiB, WS_MSUM = 900 * MiB, WS_Y = 932 * MiB, WS_X1 = 996 * MiB, WS_X1B = 1060 * MiB;
constexpr size_t WS_XCUR = 1092 * MiB, WS_HB = 1156 * MiB, WS_YEXP = 1236 * MiB, WS_LIST = 1524 * MiB, WS_WL = 1526 * MiB, WS_SLOT = 1528 * MiB, WS_MQ = 1530 * MiB, WS_MS = 1534 * MiB, WS_MK = 1538 * MiB, WS_MV = 1542 * MiB, WS_MFL = 1552 * MiB, WS_HDEN = WS_MFL + 65536, WS_VT = 1553 * MiB, WS_END = 1561 * MiB;
constexpr size_t WS_GU = WS_GQ, WS_GNW = WS_GK, WS_GQG = WS_GK + 8 * MiB, WS_GKT = WS_GV, WS_GAT = WS_GV + 8 * MiB, WS_GDL = WS_GV + 12 * MiB;
constexpr int HROWS = 73728;
static_assert(WS_HB + (size_t)HROWS * ED * 2 <= WS_YEXP && WS_YEXP + (size_t)HROWS * D * 2 <= WS_LIST, "ws map (moe)");
static_assert(WS_WIN + (size_t)ZC * D * 2 <= WS_WBR && WS_WUP + (size_t)NEX * 1024 * D * 2 <= WS_WDN && WS_WDN + (size_t)D * HK * 2 <= WS_XB, "ws map (weights)");
static_assert(WS_Z + (size_t)T * ZC * 2 <= WS_GQ, "ws map (acts)");
constexpr int CW_BAR = 4096, CW_CNT = 16384;
constexpr int TAB_OFF = 131072 + 1024;
constexpr int LDS_BYTES = 163840, MISC_OFF = 131072 + 320;

__device__ __forceinline__ float bflo(unsigned w) { return __uint_as_float(w << 16); }
__device__ __forceinline__ float bfhi(unsigned w) { return __uint_as_float(w & 0xffff0000u); }
__device__ __forceinline__ unsigned f2bf(float f) { unsigned u = __float_as_uint(f); return (u + 0x7fffu + ((u >> 16) & 1u)) >> 16; }
typedef __bf16 bf16n2 __attribute__((ext_vector_type(2))); typedef float f32n2 __attribute__((ext_vector_type(2)));
__device__ __forceinline__ unsigned pk2(float lo, float hi) { const bf16n2 v = __builtin_convertvector((f32n2){lo, hi}, bf16n2); return __builtin_bit_cast(unsigned, v); }
__device__ __forceinline__ unsigned pk4_f8(float a, float b, float c, float d, float sc) {
    a = __builtin_amdgcn_fmed3f(a * sc, -448.f, 448.f); b = __builtin_amdgcn_fmed3f(b * sc, -448.f, 448.f); c = __builtin_amdgcn_fmed3f(c * sc, -448.f, 448.f); d = __builtin_amdgcn_fmed3f(d * sc, -448.f, 448.f);
    unsigned w = 0; w = __builtin_amdgcn_cvt_pk_fp8_f32(a, b, w, false); w = __builtin_amdgcn_cvt_pk_fp8_f32(c, d, w, true); return w; }
__device__ __forceinline__ v4f ld4(const void* base, size_t idx, bool is_bf16) {
    if (is_bf16) { const v2u r = *(const v2u*)((const unsigned short*)base + idx); return (v4f){bflo(r.x), bfhi(r.x), bflo(r.y), bfhi(r.y)}; }
    return *(const v4f*)((const float*)base + idx); }
template <int CTRL> __device__ __forceinline__ float dpp(float x) { return __builtin_bit_cast(float, __builtin_amdgcn_mov_dpp(__builtin_bit_cast(int, x), CTRL, 0xf, 0xf, true)); }
__device__ __forceinline__ float sum4(float x) { x += dpp<0xB1>(x); x += dpp<0x4E>(x); return x; }
__device__ __forceinline__ float sum8(float x) { x = sum4(x); x += dpp<0x141>(x); return x; }
__device__ __forceinline__ float sum16(float x) { x = sum8(x); x += dpp<0x140>(x); return x; }
__device__ __forceinline__ float wave_sum(float x) { x = sum16(x); x += __shfl_xor(x, 16); x += __shfl_xor(x, 32); return x; }
__device__ __forceinline__ float max8(float x) { x = fmaxf(x, dpp<0xB1>(x)); x = fmaxf(x, dpp<0x4E>(x)); x = fmaxf(x, dpp<0x141>(x)); return x; }
__device__ __forceinline__ float min8(float x) { x = fminf(x, dpp<0xB1>(x)); x = fminf(x, dpp<0x4E>(x)); x = fminf(x, dpp<0x141>(x)); return x; }
__device__ __forceinline__ float wave_scan_incl(float v) {
    v += __builtin_bit_cast(float, __builtin_amdgcn_update_dpp(0, __builtin_bit_cast(int, v), 0x111, 0xf, 0xf, true));
    v += __builtin_bit_cast(float, __builtin_amdgcn_update_dpp(0, __builtin_bit_cast(int, v), 0x112, 0xf, 0xf, true));
    v += __builtin_bit_cast(float, __builtin_amdgcn_update_dpp(0, __builtin_bit_cast(int, v), 0x114, 0xf, 0xf, true));
    v += __builtin_bit_cast(float, __builtin_amdgcn_update_dpp(0, __builtin_bit_cast(int, v), 0x118, 0xf, 0xf, true));
    v += __builtin_bit_cast(float, __builtin_amdgcn_update_dpp(0, __builtin_bit_cast(int, v), 0x142, 0xa, 0xf, false));
    v += __builtin_bit_cast(float, __builtin_amdgcn_update_dpp(0, __builtin_bit_cast(int, v), 0x143, 0xc, 0xf, false));
    return v;
}
__device__ __forceinline__ float sigmoidf_(float x) { return __builtin_amdgcn_rcpf(1.f + __expf(-x)); }
__device__ __forceinline__ float sigmoid_div(float x) { return 1.f / (1.f + __expf(-x)); }
__device__ __forceinline__ float siluf_(float x) { return x * __builtin_amdgcn_rcpf(1.f + __expf(-x)); }
__device__ __forceinline__ float softplusf_(float x) { return fmaxf(x, 0.f) + __logf(1.f + __expf(-fabsf(x))); }
__device__ __forceinline__ float gelu_tanh(float x) { const float y = 0.7978845608f * (x + 0.044715f * x * x * x); const float t = 1.f - 2.f * __builtin_amdgcn_rcpf(__expf(2.f * y) + 1.f); return 0.5f * x * (1.f + t); }
__device__ __forceinline__ void unpack8(const v4u r, float (&f)[8]) { f[0] = bflo(r.x); f[1] = bfhi(r.x); f[2] = bflo(r.y); f[3] = bfhi(r.y); f[4] = bflo(r.z); f[5] = bfhi(r.z); f[6] = bflo(r.w); f[7] = bfhi(r.w); }
#define XB_TMO      128
#define XB_XCNT(j)  (256  + 64 * (j))
#define XB_XSUB(j)  (1280 + 64 * (j))
#define XB_XGEN(j)  (2304 + 64 * (j))
#define XB_TOP      3328
#define XB_TOPGEN   3392
#define XCD_BAR_WORDS 3456
#define XB_SPIN_CAP (1u << 18)

__device__ __forceinline__ unsigned xb_ld(unsigned* p)              { return __hip_atomic_load(p, __ATOMIC_RELAXED, __HIP_MEMORY_SCOPE_AGENT); }
__device__ __forceinline__ unsigned xb_add(unsigned* p, unsigned v) { return __hip_atomic_fetch_add(p, v, __ATOMIC_RELAXED, __HIP_MEMORY_SCOPE_AGENT); }
__device__ __forceinline__ unsigned xb_xcc_id() { return (unsigned)__builtin_amdgcn_s_getreg((3 << 11) | 20) & 0xFu; }
#define XB_SPIN(cond, bar) do { unsigned _sp = 0; while (cond) { __builtin_amdgcn_s_sleep(1); \
    if ((++_sp & 255u) == 0u) { if (xb_ld(&(bar)[XB_TMO])) break; if (_sp > XB_SPIN_CAP) { atomicAdd(&(bar)[XB_TMO], 1u); break; } } } } while (0)

struct XcdBarrier {
    unsigned* bar; unsigned x;
    volatile LAS unsigned* st;
};

__device__ __forceinline__ XcdBarrier xcd_barrier_post(unsigned* bar, volatile LAS unsigned* st) {
    XcdBarrier b; b.bar = bar; b.x = xb_xcc_id(); b.st = st;
    if (threadIdx.x == 0) (void)xb_add(&bar[XB_XCNT(b.x)], 1u);
    return b;
}
__device__ __forceinline__ void xcd_barrier_complete(unsigned* bar, unsigned x, unsigned& nloc, unsigned& nx) {
    const unsigned G = gridDim.x * gridDim.y * gridDim.z;
    unsigned sum, cnt, mine, sp = 0u;
    for (;;) {
        sum = 0u; cnt = 0u; mine = 0u;
#pragma unroll
        for (unsigned j = 0; j < 16; ++j) { const unsigned c = xb_ld(&bar[XB_XCNT(j)]); sum += c; cnt += (c > 0u) ? 1u : 0u; mine = (j == x) ? c : mine; }
        if (sum == G) break;
        __builtin_amdgcn_s_sleep(1);
        if ((++sp & 255u) == 0u) { if (xb_ld(&bar[XB_TMO])) break; if (sp > XB_SPIN_CAP) { atomicAdd(&bar[XB_TMO], 1u); break; } }
    }
    nloc = mine > 0u ? mine : 1u; nx = cnt > 0u ? cnt : 1u;
}

__device__ __forceinline__ void xcd_barrier(const XcdBarrier& b) {
    asm volatile("s_waitcnt vmcnt(0)" ::: "memory");
    __syncthreads();
    if (threadIdx.x == 0) {
        unsigned* bar = b.bar;
        __builtin_amdgcn_s_waitcnt(0);
        unsigned nloc = b.st[0], nx = b.st[1];
        if (nloc == 0u) { xcd_barrier_complete(bar, b.x, nloc, nx); b.st[0] = nloc; b.st[1] = nx; }
        const unsigned old = xb_add(&bar[XB_XSUB(b.x)], 1u);
        const unsigned gen = old / nloc;
        if (old + 1u == (gen + 1u) * nloc) {
            __builtin_amdgcn_fence(__ATOMIC_RELEASE, "agent");
            asm volatile("s_waitcnt vmcnt(0)" ::: "memory");
            const unsigned og = xb_add(&bar[XB_TOP], 1u);
            const unsigned tg = og / nx;
            if (og + 1u == (tg + 1u) * nx) xb_add(&bar[XB_TOPGEN], 1u);
            else XB_SPIN(xb_ld(&bar[XB_TOPGEN]) == tg, bar);
            __builtin_amdgcn_fence(__ATOMIC_ACQUIRE, "agent");
            xb_add(&bar[XB_XGEN(b.x)], 1u);
            asm volatile("s_waitcnt vmcnt(0)" ::: "memory");
        } else {
            XB_SPIN(xb_ld(&bar[XB_XGEN(b.x)]) == gen, bar);
            __builtin_amdgcn_fence(__ATOMIC_ACQUIRE, "agent");
            asm volatile("s_waitcnt vmcnt(0)" ::: "memory");
        }
    }
    __syncthreads();
}

struct Params { const float* in[27]; float* out; unsigned char* ws; int ph_lo, ph_hi; };
enum { I_X = 0, I_WIN, I_GMNG, I_GMNB, I_GMWS, I_GMBS, I_CONVW, I_ALOG, I_DTB, I_GDNNG, I_MLIB, I_MLFB, I_MLNG, I_WBR, I_WOUT, I_LN1G, I_LN1B,
       I_WR, I_RB, I_WG, I_WU, I_WD, I_SG, I_SU, I_SD, I_LN2G, I_LN2B };

using pg8::f32x4; using pg8::u32x4; using pg8::Unit; using pg8::HALF; using pg8::BM;

struct EpiMergeH {
    static constexpr bool PERM = true, AFTER_DRAIN = false; static constexpr int MID = MERGE_FP8 ? BW / (2 * pg8::BK) : BW / pg8::BK;
    const bf16* Z; bf16* msum;
    __device__ __forceinline__ void mid(f32x4 (&acc)[2][2][4][2], const Unit& u, int j, int wr, int wc, int fr, int fq) const {
        int row0 = u.pm * BM + wr * 64 + fr; const int col0 = u.pn * BM + wc * 32 + 8 * fq; asm volatile("" : "+v"(row0));
        const bf16* zp = Z + ZC_GATE + (size_t)(j - 1) * D + col0;
#pragma unroll
        for (int am = 0; am < 4; ++am) { const int ai = am >> 1, m0 = (am & 1) * 2; v4u ga[2][2], gb[2][2];
#pragma unroll
            for (int m = 0; m < 2; ++m)
#pragma unroll
                for (int bj = 0; bj < 2; ++bj) { const bf16* q = zp + (size_t)(row0 + ai * HALF + (m0 + m) * 16) * ZC + bj * HALF; ga[m][bj] = *(const v4u*)q; gb[m][bj] = *(const v4u*)(q + D); }
#pragma unroll
            for (int m = 0; m < 2; ++m)
#pragma unroll
                for (int bj = 0; bj < 2; ++bj) { float a[8], b[8]; unpack8(ga[m][bj], a); unpack8(gb[m][bj], b);
#pragma unroll
                    for (int i = 0; i < 8; ++i) { const float ea = __builtin_amdgcn_exp2f(fmaxf(a[i], -60.f) * -1.44269504f), eb = __builtin_amdgcn_exp2f(fmaxf(b[i], -60.f) * -1.44269504f);
                        acc[ai][bj][m0 + m][i >> 2][i & 3] *= (1.f + eb) * __builtin_amdgcn_rcpf(1.f + ea); } }
            asm volatile("" ::: "memory"); }
    }
    __device__ __forceinline__ void operator()(const f32x4 (&acc)[2][2][4][2], const Unit& u, int wr, int wc, int fr, int fq) const {
        const int row0 = u.pm * BM + wr * 64 + fr, col0 = u.pn * BM + wc * 32 + 8 * fq;
#pragma unroll
        for (int ai = 0; ai < 2; ++ai) { v4u gg[4][2];
#pragma unroll
            for (int m = 0; m < 4; ++m)
#pragma unroll
                for (int bj = 0; bj < 2; ++bj) gg[m][bj] = *(const v4u*)(Z + (size_t)(row0 + ai * HALF + m * 16) * ZC + ZC_GATE + 3 * D + col0 + bj * HALF);
#pragma unroll
            for (int m = 0; m < 4; ++m)
#pragma unroll
                for (int bj = 0; bj < 2; ++bj) { const size_t row = (size_t)(row0 + ai * HALF + m * 16); const int col = col0 + bj * HALF; float gl[8]; unpack8(gg[m][bj], gl);
                    f32x4 v0 = acc[ai][bj][m][0], v1 = acc[ai][bj][m][1];
#pragma unroll
                    for (int j = 0; j < 4; ++j) { v0[j] *= sigmoidf_(gl[j]) * MGSC; v1[j] *= sigmoidf_(gl[4 + j]) * MGSC; }
                    unsigned w0 = 0, w1 = 0; w0 = __builtin_amdgcn_cvt_pk_fp8_f32(v0[0], v0[1], w0, false); w0 = __builtin_amdgcn_cvt_pk_fp8_f32(v0[2], v0[3], w0, true); w1 = __builtin_amdgcn_cvt_pk_fp8_f32(v1[0], v1[1], w1, false); w1 = __builtin_amdgcn_cvt_pk_fp8_f32(v1[2], v1[3], w1, true);
                    *(v2u*)((unsigned char*)msum + row * D + col) = (v2u){w0, w1}; }
            asm volatile("" ::: "memory"); }
    }
};
struct EpiResid {
    static constexpr bool PERM = true, AFTER_DRAIN = false; static constexpr int MID = 0;
    const void* X; bf16* Y; float sc; bool xbf;
    __device__ __forceinline__ void operator()(const f32x4 (&acc)[2][2][4][2], const Unit& u, int wr, int wc, int fr, int fq) const {
        const int row0 = u.pm * BM + wr * 64 + fr, col0 = u.pn * BM + wc * 32 + 8 * fq;
#pragma unroll
        for (int ai = 0; ai < 2; ++ai)
#pragma unroll
            for (int m = 0; m < 4; ++m) { const size_t off = (size_t)(row0 + ai * HALF + m * 16) * D + col0;
#pragma unroll
                for (int bj = 0; bj < 2; ++bj) { const f32x4 x0 = ld4(X, off + bj * HALF, xbf), x1 = ld4(X, off + bj * HALF + 4, xbf);
                    const f32x4 v0 = x0 * ALPHA + acc[ai][bj][m][0] * sc, v1 = x1 * ALPHA + acc[ai][bj][m][1] * sc;
                    u32x4 w; w.x = pk2(v0[0], v0[1]); w.y = pk2(v0[2], v0[3]); w.z = pk2(v1[0], v1[1]); w.w = pk2(v1[2], v1[3]); *(u32x4*)(Y + off + bj * HALF) = w; } }
    }
};
struct MoeTab {
    LAS int* t; LAS unsigned short* tok; LAS float* wt; LAS unsigned char* mte;
    __device__ __forceinline__ MoeTab(LAS unsigned char* lds) : t((LAS int*)(lds + TAB_OFF)), tok((LAS unsigned short*)(lds + TAB_OFF + 1024)), wt((LAS float*)(lds + TAB_OFF + 5120)), mte((LAS unsigned char*)(lds + TAB_OFF + 13312)) {}
};
__device__ __forceinline__ void moe_tables(const MoeTab& M, const unsigned* cnt  , int tid, int lane, int wave) {
    __syncthreads();
    if (wave == 0) { const int c = (int)cnt[64 * lane]; const int tiles = (c + 255) >> 8; const float incl = wave_scan_incl((float)tiles);
        M.t[80 + lane] = c; M.t[lane] = (int)incl - tiles; if (lane == 63) { M.t[64] = (int)incl; M.t[65] = (int)incl + T / 256; M.t[80 + 64] = T; } }
    __syncthreads();
    const int Mt = M.t[65];
    for (int mt = tid; mt < Mt; mt += 512) { int e = 0;
        for (int k = 1; k <= 64; ++k) e = (M.t[k] <= mt) ? k : e;
        M.mte[mt] = (unsigned char)e; }
    __syncthreads();
}
struct UpOrder {
    MoeTab M; int n;
    __device__ __forceinline__ bool next(int i, Unit& u) const { if (i >= n) return false; u.pm = M.t[168 + i]; u.pn = M.t[176 + i]; u.aux = i; return true; }
    __device__ __forceinline__ int row_token(int i, int r) const { return (int)M.tok[i * 256 + r]; }
    __device__ __forceinline__ void a_ready(const Unit&) const {}
    __device__ __forceinline__ void done(const Unit&) const {}
};
__device__ __forceinline__ int up_order_build(const MoeTab& M, const int* LIST, const float* WL, int wg, int G, int tid) {
    const int U = 4 * M.t[65];
    if (tid < 8) { const int L = tid * G + wg; if (L < U) { const int mt = L >> 2, q = L & 3, e = M.mte[mt]; M.t[168 + tid] = mt; M.t[176 + tid] = e * 4 + q; M.t[184 + tid] = e; M.t[192 + tid] = mt - M.t[e]; } }
    int n = 0;
#pragma unroll
    for (int i = 0; i < 8; ++i) n += (i * G + wg < U) ? 1 : 0;
    __syncthreads();
    for (int idx = tid; idx < n * 256; idx += 512) { const int i = idx >> 8, r = idx & 255, e = M.t[184 + i], li = M.t[192 + i] * 256 + r;
        int tk = 0; float w = 0.f;
        if (e < NE) { if (li < M.t[80 + e]) { tk = LIST[e * T + li]; w = WL[e * T + li]; } } else { tk = li; w = 1.f; }
        M.tok[idx] = (unsigned short)tk; M.wt[idx] = w; }
    __syncthreads();
    return n;
}
struct EpiGluSparse {
    static constexpr bool PERM = true, AFTER_DRAIN = false; static constexpr int MID = 0;
    LAS const float* wt; bf16* H;
    __device__ __forceinline__ void operator()(const f32x4 (&acc)[2][2][4][2], const Unit& u, int wr, int wc, int fr, int fq) const {
        const int q = u.pn & 3; const int rl0 = wr * 64 + fr, col0 = q * 128 + wc * 32 + 8 * fq;
#pragma unroll
        for (int ai = 0; ai < 2; ++ai)
#pragma unroll
            for (int m = 0; m < 4; ++m) { const int rl = rl0 + ai * HALF + m * 16; const float c = wt[u.aux * 256 + rl]; float h[8];
#pragma unroll
                for (int n = 0; n < 2; ++n)
#pragma unroll
                    for (int j = 0; j < 4; ++j) h[4 * n + j] = siluf_(acc[ai][0][m][n][j] * UPSC) * (acc[ai][1][m][n][j] * UPSC) * c;
#if MOE_DN_FP8
#pragma unroll
                for (int j = 0; j < 8; ++j) h[j] = __builtin_amdgcn_fmed3f(h[j] * HSC, -448.f, 448.f);
                unsigned w0 = 0, w1 = 0; w0 = __builtin_amdgcn_cvt_pk_fp8_f32(h[0], h[1], w0, false); w0 = __builtin_amdgcn_cvt_pk_fp8_f32(h[2], h[3], w0, true); w1 = __builtin_amdgcn_cvt_pk_fp8_f32(h[4], h[5], w1, false); w1 = __builtin_amdgcn_cvt_pk_fp8_f32(h[6], h[7], w1, true);
                *(v2u*)((unsigned char*)H + ((size_t)u.pm * 256 + rl) * ED + col0) = (v2u){w0, w1}; }
#else
                u32x4 w; w.x = pk2(h[0], h[1]); w.y = pk2(h[2], h[3]); w.z = pk2(h[4], h[5]); w.w = pk2(h[6], h[7]);
                *(u32x4*)(H + ((size_t)u.pm * 256 + rl) * ED + col0) = w; }
#endif
    }
};
struct DownOrder {
    MoeTab M; int G, c, U;
    __device__ __forceinline__ bool next(int i, Unit& u) const { const int L = i * G + c; if (L >= U) return false; const int mt = L >> 3, e = (int)M.mte[mt]; u.pm = mt; u.pn = e * 8 + (L & 7); const int left = M.t[80 + e] - 256 * (mt - M.t[e]); u.aux = left < 256 ? left : 256; return true; }
    __device__ __forceinline__ void a_ready(const Unit&) const {}
    __device__ __forceinline__ void done(const Unit&) const {}
};
struct EpiYexp {
    static constexpr bool PERM = true, AFTER_DRAIN = false; static constexpr int MID = 0;
    bf16* Y;
    __device__ __forceinline__ void operator()(const f32x4 (&acc)[2][2][4][2], const Unit& u, int wr, int wc, int fr, int fq) const {
        const int row0 = u.pm * BM + wr * 64 + fr, col0 = (u.pn & 7) * BM + wc * 32 + 8 * fq;
#pragma unroll
        for (int ai = 0; ai < 2; ++ai)
#pragma unroll
            for (int m = 0; m < 4; ++m) { bf16* rowp = Y + (size_t)(row0 + ai * HALF + m * 16) * D + col0;
                if (wr * 64 + fr + ai * HALF + m * 16 >= u.aux) continue;
#pragma unroll
                for (int bj = 0; bj < 2; ++bj) { const f32x4 v0 = acc[ai][bj][m][0] * DNSC, v1 = acc[ai][bj][m][1] * DNSC;
#if YEXP_FP8
                    *(v2u*)((unsigned char*)Y + (size_t)(row0 + ai * HALF + m * 16) * D + col0 + bj * HALF) = (v2u){pk4_f8(v0[0], v0[1], v0[2], v0[3], YSC), pk4_f8(v1[0], v1[1], v1[2], v1[3], YSC)}; } }
#else
                    u32x4 w; w.x = pk2(v0[0], v0[1]); w.y = pk2(v0[2], v0[3]); w.z = pk2(v1[0], v1[1]); w.w = pk2(v1[2], v1[3]); *(u32x4*)(rowp + bj * HALF) = w; } }
#endif
    }
};

struct TrItem { const float* src; bf16* dst; unsigned sld, dld; int f8; };
__device__ __forceinline__ void tr_load(const TrItem& t, int lane, v4f (&v)[8]) { const int r8 = lane >> 3, c4 = lane & 7;
#pragma unroll
    for (int i = 0; i < 8; ++i) v[i] = *(const v4f*)(t.src + (size_t)(8 * i + r8) * t.sld + 4 * c4); }
__device__ __forceinline__ void tr_store(const TrItem& t, const v4f (&v)[8], LAS float* scr, int lane, bool nostore = false) {
    { const int r8 = lane >> 3, c4 = lane & 7;
#pragma unroll
      for (int i = 0; i < 8; ++i) { LAS float* d = scr + (8 * i + r8) * 33 + 4 * c4; d[0] = v[i].x; d[1] = v[i].y; d[2] = v[i].z; d[3] = v[i].w; } }
    LDS_WAIT(); asm volatile("" ::: "memory");
    if (nostore) return;
    if (t.f8) {
        const int c = lane & 3;
#pragma unroll
        for (int j = 0; j < 2; ++j) { const int n = (lane >> 2) + 16 * j; const LAS float* s = scr + (16 * c) * 33 + n; unsigned w[4];
#pragma unroll
            for (int q = 0; q < 4; ++q) { unsigned x = 0; x = __builtin_amdgcn_cvt_pk_fp8_f32(s[(4 * q) * 33] * 64.f, s[(4 * q + 1) * 33] * 64.f, x, false); x = __builtin_amdgcn_cvt_pk_fp8_f32(s[(4 * q + 2) * 33] * 64.f, s[(4 * q + 3) * 33] * 64.f, x, true); w[q] = x; }
            *(v4u*)((unsigned char*)t.dst + (size_t)n * t.dld + 16 * c) = (v4u){w[0], w[1], w[2], w[3]}; }
    } else {
        const int c = lane & 7;
#pragma unroll
        for (int j = 0; j < 4; ++j) { const int n = (lane >> 3) + 8 * j; const LAS float* s = scr + (8 * c) * 33 + n;
            v4u o; o.x = pk2(s[0 * 33], s[1 * 33]); o.y = pk2(s[2 * 33], s[3 * 33]); o.z = pk2(s[4 * 33], s[5 * 33]); o.w = pk2(s[6 * 33], s[7 * 33]);
            *(v4u*)(t.dst + (size_t)n * t.dld + 8 * c) = o; }
    }
    LDS_WAIT(); asm volatile("" ::: "memory");
}
template <int PART> __device__ __forceinline__ TrItem tr_decode(const Params& p, int l, int it) {
    unsigned char* ws = p.ws;
    constexpr int N_IN = (ZC / 32) * (D / 64), N_BR = 4 * (BW / 64) * (D / 32), N_OUT = (D / 64) * (D / 32), N_UP = NEX * 2 * (D / 64) * (ED / 32);
    int r = it; TrItem t; t.f8 = 0;
    if (PART == 0) {
        const float* w_in = p.in[I_WIN] + (size_t)l * D * INC; const float* w_br = p.in[I_WBR] + (size_t)l * 4 * BW * D; const float* w_out = p.in[I_WOUT] + (size_t)l * D * D;
        bf16* WIN = (bf16*)(ws + WS_WIN); bf16* WBR = (bf16*)(ws + WS_WBR); bf16* WOUT = (bf16*)(ws + WS_WOUT);
        if (r < N_IN) { const int kb = r / (ZC / 32), n0 = (r % (ZC / 32)) * 32, k0 = kb * 64; const int sc = n0 + (n0 >= ZC_GATE ? 16 : (n0 >= ZC_MLQ ? 8 : 0));
            t.src = w_in + (size_t)k0 * INC + sc; t.sld = INC; t.dst = (bf16*)((unsigned char*)WIN + (size_t)n0 * D + k0); t.dld = D; t.f8 = 1; return t; } r -= N_IN;
        if (r < N_BR) { const int g = r / 512, rr = r % 512, k0 = (rr / 64) * 64, n0 = (rr % 64) * 32;
            t.src = w_br + ((size_t)g * BW + k0) * D + n0; t.sld = D;
#if MERGE_FP8
            t.dst = (bf16*)((unsigned char*)WBR + (size_t)n0 * BRW + g * BW + k0); t.dld = BRW; t.f8 = 1; return t; }
#else
            t.dst = WBR + (size_t)n0 * BRW + g * BW + k0; t.dld = BRW; return t; }
#endif
        r -= N_BR;
        { const int k0 = (r / 64) * 64, n0 = (r % 64) * 32; t.src = w_out + (size_t)k0 * D + n0; t.sld = D; t.dst = (bf16*)((unsigned char*)WOUT + (size_t)n0 * D + k0); t.dld = D; t.f8 = 1; return t; }
    } else {
        const float* w_g = p.in[I_WG] + (size_t)l * NE * D * ED; const float* w_u = p.in[I_WU] + (size_t)l * NE * D * ED; const float* w_d = p.in[I_WD] + (size_t)l * NE * ED * D;
        const float* s_g = p.in[I_SG] + (size_t)l * D * ED; const float* s_u = p.in[I_SU] + (size_t)l * D * ED; const float* s_d = p.in[I_SD] + (size_t)l * ED * D;
        bf16* WUP = (bf16*)(ws + WS_WUP); bf16* WDN = (bf16*)(ws + WS_WDN);
        if (r < N_UP) { const int e = r / 1024, rr = r % 1024, mat = rr / 512, r2 = rr % 512, k0 = (r2 / 16) * 64, n0 = (r2 % 16) * 32;
            const float* sb = (e < NE) ? ((mat ? w_u : w_g) + (size_t)e * D * ED) : (mat ? s_u : s_g);
            const int drow = e * 1024 + (n0 / 128) * 256 + mat * 128 + (n0 % 128);
            t.src = sb + (size_t)k0 * ED + n0; t.sld = ED;
#if MOE_UP_FP8
            t.dst = (bf16*)((unsigned char*)WUP + (size_t)drow * D + k0); t.dld = D; t.f8 = 1; return t; }
#else
            t.dst = WUP + (size_t)drow * D + k0; t.dld = D; return t; }
#endif
        r -= N_UP;
        { const int e = r / 512, rr = r % 512, k0 = (rr / 64) * 64, n0 = (rr % 64) * 32;
            const float* sb = (e < NE) ? (w_d + (size_t)e * ED * D) : s_d;
            t.src = sb + (size_t)k0 * D + n0; t.sld = D;
#if MOE_DN_FP8
            t.dst = (bf16*)((unsigned char*)WDN + ((size_t)e * D + n0) * ED + k0); t.dld = ED; t.f8 = 1; return t; }
#else
            t.dst = WDN + ((size_t)e * D + n0) * ED + k0; t.dld = ED; return t; }
#endif
    }
}
template <int PART> __device__ __forceinline__ void phase_convert(const Params& p, int l, LAS unsigned char* lds, int gw, int NGW, int wave, int lane, bool nostore = false, int lo = 0, int hi = 1 << 30) {
    constexpr int N_IN = (ZC / 32) * (D / 64), N_BR = 4 * (BW / 64) * (D / 32), N_OUT = (D / 64) * (D / 32), N_UP = NEX * 2 * (D / 64) * (ED / 32), N_DN = NEX * (ED / 64) * (D / 32);
    constexpr int NITEMS = (PART == 0) ? (N_IN + N_BR + N_OUT) : (N_UP + N_DN);
    LAS float* scr = (LAS float*)(lds + wave * 16384);
    const int NIT = hi < NITEMS ? hi : NITEMS;
    if (lo + gw >= NIT) return;
    TrItem cur = tr_decode<PART>(p, l, lo + gw); v4f va[8], vb[8];
    tr_load(cur, lane, va);
    for (int it = lo + gw; it < NIT; it += 2 * NGW) {
        const int i1 = it + NGW, i2 = it + 2 * NGW; TrItem nx = cur;
        if (i1 < NIT) { nx = tr_decode<PART>(p, l, i1); } tr_load(nx, lane, vb);
        tr_store(cur, va, scr, lane, nostore);
        if (i1 >= NIT) break;
        cur = nx; if (i2 < NIT) { cur = tr_decode<PART>(p, l, i2); } tr_load(cur, lane, va);
        tr_store(nx, vb, scr, lane, nostore);
        if (i2 >= NIT) break;
    }
}
__device__ __forceinline__ void phase_xprep(const Params& p, int l, const void* xin, bool xbf, LAS unsigned char* lds, int gw, int NGW, int tid, int lane) {
    const float* w_in = p.in[I_WIN] + (size_t)l * D * INC;
    constexpr int XP = 2052; LAS float* xt = (LAS float*)lds; LAS float* part = (LAS float*)lds;
    const int wave = tid >> 6, n_l = lane & 15, kq = lane >> 4, wg = gw >> 3, G = NGW >> 3;
    const int colw = n_l < 8 ? 4608 + n_l : 6152 + (n_l - 8);
    float bw[64];
#pragma unroll
    for (int q = 0; q < 64; ++q) bw[q] = w_in[(size_t)(256 * wave + 16 * (q >> 2) + 4 * kq + (q & 3)) * INC + colw];
    unsigned char* XB = p.ws + WS_XB; float* SMALL = (float*)(p.ws + WS_SMALL);
    __syncthreads();
    for (int tg = wg; tg < T / 16; tg += G) {
        {   v4f va[8], vb[8]; const size_t m0 = (size_t)tg * 16 + 2 * wave;
#pragma unroll
            for (int j = 0; j < 8; ++j) { va[j] = ld4(xin, m0 * D + 4 * lane + 256 * j, xbf); vb[j] = ld4(xin, (m0 + 1) * D + 4 * lane + 256 * j, xbf); }
#pragma unroll
            for (int rr = 0; rr < 2; ++rr) { unsigned* xo = (unsigned*)(XB + (m0 + rr) * D) + lane;
#pragma unroll
                for (int j = 0; j < 8; ++j) { const v4f v = rr ? vb[j] : va[j]; unsigned w = 0; w = __builtin_amdgcn_cvt_pk_fp8_f32(v.x, v.y, w, false); w = __builtin_amdgcn_cvt_pk_fp8_f32(v.z, v.w, w, true); xo[64 * j] = w;
                    *(LAS v4f*)(xt + (2 * wave + rr) * XP + 4 * lane + 256 * j) = v; } } }
        __syncthreads();
        {   pg8::f32x4 acc[4];
#pragma unroll
            for (int i = 0; i < 4; ++i) acc[i] = (pg8::f32x4){0.f, 0.f, 0.f, 0.f};
            const LAS float* xa = xt + n_l * XP + 256 * wave + 4 * kq;
#pragma unroll
            for (int s2 = 0; s2 < 16; ++s2) { const v4f a4 = *(const LAS v4f*)(xa + 16 * s2);
                acc[0] = __builtin_amdgcn_mfma_f32_16x16x4f32(a4.x, bw[4 * s2 + 0], acc[0], 0, 0, 0); acc[1] = __builtin_amdgcn_mfma_f32_16x16x4f32(a4.y, bw[4 * s2 + 1], acc[1], 0, 0, 0);
                acc[2] = __builtin_amdgcn_mfma_f32_16x16x4f32(a4.z, bw[4 * s2 + 2], acc[2], 0, 0, 0); acc[3] = __builtin_amdgcn_mfma_f32_16x16x4f32(a4.w, bw[4 * s2 + 3], acc[3], 0, 0, 0); }
            const pg8::f32x4 tot = (acc[0] + acc[1]) + (acc[2] + acc[3]);
            __syncthreads();
#pragma unroll
            for (int j = 0; j < 4; ++j) part[(wave * 16 + 4 * kq + j) * 16 + n_l] = tot[j]; }
        __syncthreads();
        if (tid < 256) { float a = 0.f;
#pragma unroll
            for (int w = 0; w < 8; ++w) a += part[w * 256 + tid];
            SMALL[(size_t)tg * 256 + tid] = a; }
        __syncthreads();
    }
}


typedef short bf16x8_t __attribute__((ext_vector_type(8)));
__device__ __forceinline__ void ml_pre_item(const Params& p, int l, LAS unsigned char* lds, int item, int tid, int wave, int lane) {
    const int h = item & 3, n = item >> 2; const size_t t0 = (size_t)n * 64;
    const bf16* Z = (const bf16*)(p.ws + WS_Z); const float* SMALL = (const float*)(p.ws + WS_SMALL);
    bf16* MQ = (bf16*)(p.ws + WS_MQ) + (size_t)item * 4096; bf16* MS = (bf16*)(p.ws + WS_MS) + (size_t)item * 4096; bf16* MK = (bf16*)(p.ws + WS_MK) + (size_t)item * 4096;
    bf16* MV = (bf16*)(p.ws + WS_MV) + (size_t)item * 9216; float* MFL = (float*)(p.ws + WS_MFL);
    LAS float* qs = (LAS float*)lds;
    LAS float* ks = qs + 64 * 65;
    LAS float* bs = ks + 64 * 65;
    LAS unsigned short* vs = (LAS unsigned short*)(bs + 128);
    { const int tk = tid >> 3, c8 = tid & 7; float f[8];
      unpack8(*(const v4u*)(Z + (t0 + tk) * ZC + ZC_MLQ + h * 64 + 8 * c8), f);
#pragma unroll
      for (int i = 0; i < 8; ++i) qs[tk * 65 + 8 * c8 + i] = f[i];
      unpack8(*(const v4u*)(Z + (t0 + tk) * ZC + ZC_MLK + h * 64 + 8 * c8), f);
#pragma unroll
      for (int i = 0; i < 8; ++i) ks[tk * 65 + 8 * c8 + i] = f[i]; }
#pragma unroll
    for (int r = 0; r < 2; ++r) { const int idx = tid + 512 * r, tk = idx >> 4, c8 = idx & 15;
        *(LAS v4u*)(vs + tk * 136 + 8 * c8) = *(const v4u*)(Z + (t0 + tk) * ZC + ZC_MLV + h * 128 + 8 * c8); }
    if (wave == 0) { const float fp = SMALL[(t0 + lane) * 16 + 12 + h] + p.in[I_MLFB][l * 4 + h]; const float lf = -softplusf_(-fp);
        bs[lane] = wave_scan_incl(lf); bs[64 + lane] = SMALL[(t0 + lane) * 16 + 8 + h] + p.in[I_MLIB][l * 4 + h]; }
    __syncthreads();
    const float blast = bs[63];
    { const int i = tid >> 3, jb = tid & 7; const float bi = bs[i];
      { const float e = __expf(bi) * 0.125f; float o[8];
#pragma unroll
        for (int x = 0; x < 8; ++x) o[x] = qs[i * 65 + 8 * jb + x] * e;
        v4u w; w.x = pk2(o[0], o[1]); w.y = pk2(o[2], o[3]); w.z = pk2(o[4], o[5]); w.w = pk2(o[6], o[7]); *(v4u*)(MQ + i * 64 + 8 * jb) = w; }
      {
          const int ti = wave >> 1, c16 = lane & 15, g4 = lane >> 4, i2 = 16 * ti + c16; const float bi2 = bs[i2];
#define ML_F8(dst, base) do { const LAS float* _b = (base); const v4u _w = (v4u){pg8::cvt_pk_bf16(_b[0], _b[1]), pg8::cvt_pk_bf16(_b[2], _b[3]), pg8::cvt_pk_bf16(_b[4], _b[5]), pg8::cvt_pk_bf16(_b[6], _b[7])}; dst = __builtin_bit_cast(bf16x8_t, _w); } while (0)
          bf16x8_t bq[2];
#pragma unroll
          for (int s2 = 0; s2 < 2; ++s2) ML_F8(bq[s2], qs + i2 * 65 + 32 * s2 + 8 * g4);
#pragma unroll
          for (int jj = 0; jj < 2; ++jj) { const int tj = 2 * (wave & 1) + jj; v2u sw = (v2u){0u, 0u};
              if (tj <= ti) { pg8::f32x4 d = {0.f, 0.f, 0.f, 0.f};
#pragma unroll
                  for (int s2 = 0; s2 < 2; ++s2) { bf16x8_t a; ML_F8(a, ks + (16 * tj + c16) * 65 + 32 * s2 + 8 * g4); d = __builtin_amdgcn_mfma_f32_16x16x32_bf16(a, bq[s2], d, 0, 0, 0); }
                  float v4[4];
#pragma unroll
                  for (int r = 0; r < 4; ++r) { const int j = 16 * tj + 4 * g4 + r; v4[r] = (j <= i2) ? __expf(bi2 - bs[j] + bs[64 + j]) * d[r] * 0.125f : 0.f; }
                  sw = (v2u){pk2(v4[0], v4[1]), pk2(v4[2], v4[3])}; }
              *(v2u*)(MS + i2 * 64 + 16 * tj + 4 * g4) = sw; }
#undef ML_F8
      }
      { float o[8];
#pragma unroll
        for (int x = 0; x < 8; ++x) { const int j = 8 * jb + x; o[x] = ks[j * 65 + i] * __expf(blast - bs[j] + bs[64 + j]); }
        v4u w; w.x = pk2(o[0], o[1]); w.y = pk2(o[2], o[3]); w.z = pk2(o[4], o[5]); w.w = pk2(o[6], o[7]); *(v4u*)(MK + i * 64 + 8 * jb) = w; }
    }
    { const int c = tid >> 2, jq = tid & 3; unsigned w[8];
#pragma unroll
      for (int x = 0; x < 8; ++x) w[x] = (unsigned)vs[(16 * jq + 2 * x) * 136 + c] | ((unsigned)vs[(16 * jq + 2 * x + 1) * 136 + c] << 16);
      *(v4u*)(MV + c * 64 + 16 * jq) = (v4u){w[0], w[1], w[2], w[3]}; *(v4u*)(MV + c * 64 + 16 * jq + 8) = (v4u){w[4], w[5], w[6], w[7]};
      if (tid < 64) { const int c2 = 128 + (tid >> 2); const unsigned one = (c2 == 128) ? 0x3F803F80u : 0u;
          *(v4u*)(MV + c2 * 64 + 16 * jq) = (v4u){one, one, one, one}; *(v4u*)(MV + c2 * 64 + 16 * jq + 8) = (v4u){one, one, one, one}; } }
    if (tid == 0) MFL[item] = __expf(blast);
    __syncthreads();
}
struct MlFrags { bf16x8_t q[2], s[2], kt[2], vt[2]; float fl; };
__device__ __forceinline__ void ml_load(MlFrags& F, const Params& p, int item, int offA, int offV) {
    const bf16* MQ = (const bf16*)(p.ws + WS_MQ) + (size_t)item * 4096; const bf16* MS = (const bf16*)(p.ws + WS_MS) + (size_t)item * 4096; const bf16* MK = (const bf16*)(p.ws + WS_MK) + (size_t)item * 4096;
    const bf16* MV = (const bf16*)(p.ws + WS_MV) + (size_t)item * 9216;
#pragma unroll
    for (int ks = 0; ks < 2; ++ks) { F.q[ks] = *(const bf16x8_t*)(MQ + offA + 32 * ks); F.s[ks] = *(const bf16x8_t*)(MS + offA + 32 * ks); F.kt[ks] = *(const bf16x8_t*)(MK + offA + 32 * ks); F.vt[ks] = *(const bf16x8_t*)(MV + offV + 32 * ks); }
    F.fl = ((const float*)(p.ws + WS_MFL))[item];
}
__device__ __forceinline__ void ml_seq(const Params& p, LAS unsigned char* lds, int wgi, int wave, int lane) {
    const int u = wgi * 2 + (wave >> 2), wi = wave & 3, h = u / 9, sl = u % 9, g = lane >> 4, c = lane & 15;
    LAS unsigned short* CT = (LAS unsigned short*)(lds + (wave >> 2) * 4096);
    float* HO = (float*)(p.ws + WS_HO); float* HDEN = (float*)(p.ws + WS_HDEN);
    const int offA = (16 * wi + c) * 64 + 8 * g, offV = (16 * sl + c) * 64 + 8 * g;
    *(LAS v2u*)(CT + c * 64 + 16 * wi + 4 * g) = (v2u){0u, 0u};
    pg8::f32x4 Cacc = {0.f, 0.f, 0.f, 0.f};
    __syncthreads();
    MlFrags F0, F1;
    ml_load(F0, p, h, offA, offV);
#define ML_STEP(F, n_) do { const int cur = (n_) & 1; \
        const bf16x8_t c0 = *(const LAS bf16x8_t*)(CT + cur * 1024 + c * 64 + 8 * g), c1 = *(const LAS bf16x8_t*)(CT + cur * 1024 + c * 64 + 32 + 8 * g); \
        pg8::f32x4 num = {0.f, 0.f, 0.f, 0.f}; \
        num = __builtin_amdgcn_mfma_f32_16x16x32_bf16(F.q[0], c0, num, 0, 0, 0); num = __builtin_amdgcn_mfma_f32_16x16x32_bf16(F.q[1], c1, num, 0, 0, 0); \
        num = __builtin_amdgcn_mfma_f32_16x16x32_bf16(F.s[0], F.vt[0], num, 0, 0, 0); num = __builtin_amdgcn_mfma_f32_16x16x32_bf16(F.s[1], F.vt[1], num, 0, 0, 0); \
        Cacc = Cacc * F.fl; \
        Cacc = __builtin_amdgcn_mfma_f32_16x16x32_bf16(F.kt[0], F.vt[0], Cacc, 0, 0, 0); Cacc = __builtin_amdgcn_mfma_f32_16x16x32_bf16(F.kt[1], F.vt[1], Cacc, 0, 0, 0); \
        { v2u w; w.x = pk2(Cacc[0], Cacc[1]); w.y = pk2(Cacc[2], Cacc[3]); *(LAS v2u*)(CT + (cur ^ 1) * 1024 + c * 64 + 16 * wi + 4 * g) = w; } \
        { const size_t tb = (size_t)(n_) * 64 + 16 * wi + 4 * g; \
          if (sl < 8) { _Pragma("unroll") for (int r = 0; r < 4; ++r) HO[(tb + r) * BW + h * 128 + 16 * sl + c] = num[r]; } \
          else if (c == 0) { _Pragma("unroll") for (int r = 0; r < 4; ++r) HDEN[(tb + r) * 4 + h] = num[r]; } } \
        LDS_BAR(); } while (0)
    for (int n = 0; n < T / 64; n += 2) {
        ml_load(F1, p, (n + 1) * 4 + h, offA, offV);
        ML_STEP(F0, n);
        ml_load(F0, p, ((n + 2 < T / 64) ? n + 2 : n) * 4 + h, offA, offV);
        ML_STEP(F1, n + 1);
    }
#undef ML_STEP
}


constexpr int QP = 132;
__device__ __forceinline__ void gdn_pre_item(const Params& p, int l, LAS unsigned char* lds, int item, int tid, int wave, int lane) {
    const int h = item & 3, n = item >> 2; const size_t t0 = (size_t)n * 64;
    const bf16* Z = (const bf16*)(p.ws + WS_Z); const float* SMALL = (const float*)(p.ws + WS_SMALL);
    float* GU = (float*)(p.ws + WS_GU) + (size_t)item * 8192; bf16* GNW = (bf16*)(p.ws + WS_GNW) + (size_t)item * 8192; bf16* GQG = (bf16*)(p.ws + WS_GQG) + (size_t)item * 8192;
    bf16* GAT = (bf16*)(p.ws + WS_GAT) + (size_t)item * 4096; bf16* GKT = (bf16*)(p.ws + WS_GKT) + (size_t)item * 8192; float* GDL = (float*)(p.ws + WS_GDL);
    const float* cw = p.in[I_CONVW] + (size_t)l * 4 * 1536;
    LAS float* qs = (LAS float*)lds; LAS float* ks = qs + 64 * QP; LAS float* vs = ks + 64 * QP; LAS float* Ls = vs + 64 * QP;   LAS float* gcs = Ls + 64 * 68; LAS float* bts = gcs + 64; LAS float* btg = bts + 64;
    LAS unsigned short* zq = (LAS unsigned short*)(lds + 131584); LAS unsigned short* zk = (LAS unsigned short*)Ls; LAS unsigned short* zv = (LAS unsigned short*)vs; LAS float* cwl = btg + 64;
    float gate_b = 0.f, gate_a = 0.f; if (wave == 0) { gate_b = SMALL[(t0 + lane) * 16 + h]; gate_a = SMALL[(t0 + lane) * 16 + 4 + h]; }
    {   v4u zr[7]; v4f wr4 = (v4f){0.f, 0.f, 0.f, 0.f};
#pragma unroll
        for (int q = 0; q < 7; ++q) { const int idx = tid + 512 * q; zr[q] = (v4u){0u, 0u, 0u, 0u};
            if (idx < 3216) { const int seg = idx / 1072, rem = idx % 1072, r = rem >> 4, c16 = rem & 15; const long tt = (long)t0 - 3 + r;
                if (tt >= 0) zr[q] = *(const v4u*)(Z + (size_t)tt * ZC + ZC_GDN + seg * 512 + h * 128 + 8 * c16); } }
        if (tid < 384) { const int j = tid / 96, rest = tid % 96, i = rest >> 5, c4 = rest & 31; wr4 = *(const v4f*)(cw + j * 1536 + i * 512 + h * 128 + 4 * c4); }
#pragma unroll
        for (int q = 0; q < 7; ++q) { const int idx = tid + 512 * q;
            if (idx < 3216) { const int seg = idx / 1072, rem = idx % 1072; LAS unsigned short* zb = seg == 0 ? zq : (seg == 1 ? zk : zv); *(LAS v4u*)(zb + 8 * rem) = zr[q]; } }
        if (tid < 384) *(LAS v4f*)(cwl + 4 * tid) = wr4;
    }
    __syncthreads();
    { const int tk = tid >> 3, part = tid & 7; float av[16];
#pragma unroll 1
      for (int i = 0; i < 3; ++i) { float a[16]; const LAS unsigned short* zb = i == 0 ? zq : (i == 1 ? zk : zv);
#pragma unroll
        for (int x = 0; x < 16; ++x) a[x] = 0.f;
#pragma unroll
        for (int j = 0; j < 4; ++j) { const LAS unsigned short* src = zb + (tk + j) * 128 + 16 * part; float x0[8], x1[8]; unpack8(*(const LAS v4u*)src, x0); unpack8(*(const LAS v4u*)(src + 8), x1);
            const LAS float* wp = cwl + (j * 3 + i) * 128 + 16 * part;
#pragma unroll
            for (int x4 = 0; x4 < 2; ++x4) { const v4f w0 = *(const LAS v4f*)(wp + 4 * x4), w1 = *(const LAS v4f*)(wp + 8 + 4 * x4);
                a[4 * x4] += w0.x * x0[4 * x4]; a[4 * x4 + 1] += w0.y * x0[4 * x4 + 1]; a[4 * x4 + 2] += w0.z * x0[4 * x4 + 2]; a[4 * x4 + 3] += w0.w * x0[4 * x4 + 3];
                a[8 + 4 * x4] += w1.x * x1[4 * x4]; a[8 + 4 * x4 + 1] += w1.y * x1[4 * x4 + 1]; a[8 + 4 * x4 + 2] += w1.z * x1[4 * x4 + 2]; a[8 + 4 * x4 + 3] += w1.w * x1[4 * x4 + 3]; } }
        float ss = 0.f;
#pragma unroll
        for (int x = 0; x < 16; ++x) { a[x] = siluf_(a[x]); ss += a[x] * a[x]; }
        if (i < 2) { ss = sum8(ss); const float r = rsqrtf(ss + 1e-6f) * (i == 0 ? 0.08838834764831845f : 1.f);
#pragma unroll
            for (int x = 0; x < 16; ++x) a[x] *= r;
            LAS float* dst = (i == 0 ? qs : ks) + tk * QP + 16 * part;
#pragma unroll
            for (int x4 = 0; x4 < 4; ++x4) *(LAS v4f*)(dst + 4 * x4) = (v4f){a[4 * x4], a[4 * x4 + 1], a[4 * x4 + 2], a[4 * x4 + 3]}; }
        else {
#pragma unroll
            for (int x = 0; x < 16; ++x) av[x] = a[x]; } }
      __syncthreads();
      { LAS float* dst = vs + tk * QP + 16 * part;
#pragma unroll
        for (int x4 = 0; x4 < 4; ++x4) *(LAS v4f*)(dst + 4 * x4) = (v4f){av[4 * x4], av[4 * x4 + 1], av[4 * x4 + 2], av[4 * x4 + 3]}; } }
    if (wave == 0) { const float bb = gate_b, aa = gate_a;
        const float g = -__expf(p.in[I_ALOG][l * 4 + h]) * softplusf_(aa + p.in[I_DTB][l * 4 + h]);
        const float gc = wave_scan_incl(g), bt = sigmoidf_(bb); gcs[lane] = gc; bts[lane] = bt; btg[lane] = bt * __expf(gc); }
    __syncthreads();
    { const int ti = wave >> 1, c16 = lane & 15, g4 = lane >> 4, i = 16 * ti + c16; const float gi = gcs[i], bi = bts[i];
#define GDN_F8(dst, base) do { const v4f _a = *(const LAS v4f*)(base), _b = *(const LAS v4f*)((base) + 4); const v4u _w = (v4u){pg8::cvt_pk_bf16(_a.x, _a.y), pg8::cvt_pk_bf16(_a.z, _a.w), pg8::cvt_pk_bf16(_b.x, _b.y), pg8::cvt_pk_bf16(_b.z, _b.w)}; dst = __builtin_bit_cast(bf16x8_t, _w); } while (0)
      bf16x8_t bk[4], bq[4];
#pragma unroll
      for (int s4 = 0; s4 < 4; ++s4) { GDN_F8(bk[s4], ks + i * QP + 32 * s4 + 8 * g4); GDN_F8(bq[s4], qs + i * QP + 32 * s4 + 8 * g4); }
#pragma unroll
      for (int jj = 0; jj < 2; ++jj) { const int tj = 2 * (wave & 1) + jj; v4f lv = (v4f){0.f, 0.f, 0.f, 0.f}; v2u aw = (v2u){0u, 0u};
          if (tj <= ti) { pg8::f32x4 dk = {0.f, 0.f, 0.f, 0.f}, dq = {0.f, 0.f, 0.f, 0.f};
#pragma unroll
              for (int s4 = 0; s4 < 4; ++s4) { bf16x8_t a; GDN_F8(a, ks + (16 * tj + c16) * QP + 32 * s4 + 8 * g4);
                  dk = __builtin_amdgcn_mfma_f32_16x16x32_bf16(a, bk[s4], dk, 0, 0, 0); dq = __builtin_amdgcn_mfma_f32_16x16x32_bf16(a, bq[s4], dq, 0, 0, 0); }
              float l4[4], a4[4];
#pragma unroll
              for (int r = 0; r < 4; ++r) { const int j = 16 * tj + 4 * g4 + r; const float dc = __expf(gi - gcs[j]); l4[r] = (j < i) ? bi * dk[r] * dc : 0.f; a4[r] = (j <= i) ? dq[r] * dc : 0.f; }
              lv = (v4f){l4[0], l4[1], l4[2], l4[3]}; aw = (v2u){pk2(a4[0], a4[1]), pk2(a4[2], a4[3])}; }
          *(LAS v4f*)(Ls + i * 68 + 16 * tj + 4 * g4) = lv; *(v2u*)(GAT + i * 64 + 16 * tj + 4 * g4) = aw; }
#undef GDN_F8
    }
    __syncthreads();
    if (tid < 256) {
        const int c = tid; int vz; asm volatile("v_mov_b32 %0, 0" : "=v"(vz));
        const LAS float* rp = (c < 128) ? (vs + c) : (ks + (c - 128)); const LAS float* mp = ((c < 128) ? bts : btg) + vz;
#define GDN_RHS(i) (rp[(i) * QP] * mp[(i)])
#define GDN_L4(i, j4) (*(const LAS v4f*)(Ls + (i) * 68 + 4 * (j4) + vz))
        float x0 = GDN_RHS(0); __builtin_amdgcn_sched_barrier(0);
        float x1 = GDN_RHS(1); { const v4f l0 = GDN_L4(1, 0); __builtin_amdgcn_sched_barrier(0); x1 -= l0.x * x0; } __builtin_amdgcn_sched_barrier(0);
        float x2 = GDN_RHS(2); { const v4f l0 = GDN_L4(2, 0); __builtin_amdgcn_sched_barrier(0); x2 -= l0.x * x0; x2 -= l0.y * x1; } __builtin_amdgcn_sched_barrier(0);
        float x3 = GDN_RHS(3); { const v4f l0 = GDN_L4(3, 0); __builtin_amdgcn_sched_barrier(0); x3 -= l0.x * x0; x3 -= l0.y * x1; x3 -= l0.z * x2; } __builtin_amdgcn_sched_barrier(0);
        float x4 = GDN_RHS(4); { const v4f l0 = GDN_L4(4, 0); __builtin_amdgcn_sched_barrier(0); x4 -= l0.x * x0; x4 -= l0.y * x1; x4 -= l0.z * x2; x4 -= l0.w * x3; } __builtin_amdgcn_sched_barrier(0);
        float x5 = GDN_RHS(5); { const v4f l0 = GDN_L4(5, 0); const v4f l1 = GDN_L4(5, 1); __builtin_amdgcn_sched_barrier(0); x5 -= l0.x * x0; x5 -= l0.y * x1; x5 -= l0.z * x2; x5 -= l0.w * x3; x5 -= l1.x * x4; } __builtin_amdgcn_sched_barrier(0);
        float x6 = GDN_RHS(6); { const v4f l0 = GDN_L4(6, 0); const v4f l1 = GDN_L4(6, 1); __builtin_amdgcn_sched_barrier(0); x6 -= l0.x * x0; x6 -= l0.y * x1; x6 -= l0.z * x2; x6 -= l0.w * x3; x6 -= l1.x * x4; x6 -= l1.y * x5; } __builtin_amdgcn_sched_barrier(0);
        float x7 = GDN_RHS(7); { const v4f l0 = GDN_L4(7, 0); const v4f l1 = GDN_L4(7, 1); __builtin_amdgcn_sched_barrier(0); x7 -= l0.x * x0; x7 -= l0.y * x1; x7 -= l0.z * x2; x7 -= l0.w * x3; x7 -= l1.x * x4; x7 -= l1.y * x5; x7 -= l1.z * x6; } __builtin_amdgcn_sched_barrier(0);
        float x8 = GDN_RHS(8); { const v4f l0 = GDN_L4(8, 0); const v4f l1 = GDN_L4(8, 1); __builtin_amdgcn_sched_barrier(0); x8 -= l0.x * x0; x8 -= l0.y * x1; x8 -= l0.z * x2; x8 -= l0.w * x3; x8 -= l1.x * x4; x8 -= l1.y * x5; x8 -= l1.z * x6; x8 -= l1.w * x7; } __builtin_amdgcn_sched_barrier(0);
        float x9 = GDN_RHS(9); { const v4f l0 = GDN_L4(9, 0); const v4f l1 = GDN_L4(9, 1); const v4f l2 = GDN_L4(9, 2); __builtin_amdgcn_sched_barrier(0); x9 -= l0.x * x0; x9 -= l0.y * x1; x9 -= l0.z * x2; x9 -= l0.w * x3; x9 -= l1.x * x4; x9 -= l1.y * x5; x9 -= l1.z * x6; x9 -= l1.w * x7; x9 -= l2.x * x8; } __builtin_amdgcn_sched_barrier(0);
        float x10 = GDN_RHS(10); { const v4f l0 = GDN_L4(10, 0); const v4f l1 = GDN_L4(10, 1); const v4f l2 = GDN_L4(10, 2); __builtin_amdgcn_sched_barrier(0); x10 -= l0.x * x0; x10 -= l0.y * x1; x10 -= l0.z * x2; x10 -= l0.w * x3; x10 -= l1.x * x4; x10 -= l1.y * x5; x10 -= l1.z * x6; x10 -= l1.w * x7; x10 -= l2.x * x8; x10 -= l2.y * x9; } __builtin_amdgcn_sched_barrier(0);
        float x11 = GDN_RHS(11); { const v4f l0 = GDN_L4(11, 0); const v4f l1 = GDN_L4(11, 1); const v4f l2 = GDN_L4(11, 2); __builtin_amdgcn_sched_barrier(0); x11 -= l0.x * x0; x11 -= l0.y * x1; x11 -= l0.z * x2; x11 -= l0.w * x3; x11 -= l1.x * x4; x11 -= l1.y * x5; x11 -= l1.z * x6; x11 -= l1.w * x7; x11 -= l2.x * x8; x11 -= l2.y * x9; x11 -= l2.z * x10; } __builtin_amdgcn_sched_barrier(0);
        float x12 = GDN_RHS(12); { const v4f l0 = GDN_L4(12, 0); const v4f l1 = GDN_L4(12, 1); const v4f l2 = GDN_L4(12, 2); __builtin_amdgcn_sched_barrier(0); x12 -= l0.x * x0; x12 -= l0.y * x1; x12 -= l0.z * x2; x12 -= l0.w * x3; x12 -= l1.x * x4; x12 -= l1.y * x5; x12 -= l1.z * x6; x12 -= l1.w * x7; x12 -= l2.x * x8; x12 -= l2.y * x9; x12 -= l2.z * x10; x12 -= l2.w * x11; } __builtin_amdgcn_sched_barrier(0);
        float x13 = GDN_RHS(13); { const v4f l0 = GDN_L4(13, 0); const v4f l1 = GDN_L4(13, 1); const v4f l2 = GDN_L4(13, 2); const v4f l3 = GDN_L4(13, 3); __builtin_amdgcn_sched_barrier(0); x13 -= l0.x * x0; x13 -= l0.y * x1; x13 -= l0.z * x2; x13 -= l0.w * x3; x13 -= l1.x * x4; x13 -= l1.y * x5; x13 -= l1.z * x6; x13 -= l1.w * x7; x13 -= l2.x * x8; x13 -= l2.y * x9; x13 -= l2.z * x10; x13 -= l2.w * x11; x13 -= l3.x * x12; } __builtin_amdgcn_sched_barrier(0);
        float x14 = GDN_RHS(14); { const v4f l0 = GDN_L4(14, 0); const v4f l1 = GDN_L4(14, 1); const v4f l2 = GDN_L4(14, 2); const v4f l3 = GDN_L4(14, 3); __builtin_amdgcn_sched_barrier(0); x14 -= l0.x * x0; x14 -= l0.y * x1; x14 -= l0.z * x2; x14 -= l0.w * x3; x14 -= l1.x * x4; x14 -= l1.y * x5; x14 -= l1.z * x6; x14 -= l1.w * x7; x14 -= l2.x * x8; x14 -= l2.y * x9; x14 -= l2.z * x10; x14 -= l2.w * x11; x14 -= l3.x * x12; x14 -= l3.y * x13; } __builtin_amdgcn_sched_barrier(0);
        float x15 = GDN_RHS(15); { const v4f l0 = GDN_L4(15, 0); const v4f l1 = GDN_L4(15, 1); const v4f l2 = GDN_L4(15, 2); const v4f l3 = GDN_L4(15, 3); __builtin_amdgcn_sched_barrier(0); x15 -= l0.x * x0; x15 -= l0.y * x1; x15 -= l0.z * x2; x15 -= l0.w * x3; x15 -= l1.x * x4; x15 -= l1.y * x5; x15 -= l1.z * x6; x15 -= l1.w * x7; x15 -= l2.x * x8; x15 -= l2.y * x9; x15 -= l2.z * x10; x15 -= l2.w * x11; x15 -= l3.x * x12; x15 -= l3.y * x13; x15 -= l3.z * x14; } __builtin_amdgcn_sched_barrier(0);
        float x16 = GDN_RHS(16); { const v4f l0 = GDN_L4(16, 0); const v4f l1 = GDN_L4(16, 1); const v4f l2 = GDN_L4(16, 2); const v4f l3 = GDN_L4(16, 3); __builtin_amdgcn_sched_barrier(0); x16 -= l0.x * x0; x16 -= l0.y * x1; x16 -= l0.z * x2; x16 -= l0.w * x3; x16 -= l1.x * x4; x16 -= l1.y * x5; x16 -= l1.z * x6; x16 -= l1.w * x7; x16 -= l2.x * x8; x16 -= l2.y * x9; x16 -= l2.z * x10; x16 -= l2.w * x11; x16 -= l3.x * x12; x16 -= l3.y * x13; x16 -= l3.z * x14; x16 -= l3.w * x15; } __builtin_amdgcn_sched_barrier(0);
        float x17 = GDN_RHS(17); { const v4f l0 = GDN_L4(17, 0); const v4f l1 = GDN_L4(17, 1); const v4f l2 = GDN_L4(17, 2); const v4f l3 = GDN_L4(17, 3); const v4f l4 = GDN_L4(17, 4); __builtin_amdgcn_sched_barrier(0); x17 -= l0.x * x0; x17 -= l0.y * x1; x17 -= l0.z * x2; x17 -= l0.w * x3; x17 -= l1.x * x4; x17 -= l1.y * x5; x17 -= l1.z * x6; x17 -= l1.w * x7; x17 -= l2.x * x8; x17 -= l2.y * x9; x17 -= l2.z * x10; x17 -= l2.w * x11; x17 -= l3.x * x12; x17 -= l3.y * x13; x17 -= l3.z * x14; x17 -= l3.w * x15; x17 -= l4.x * x16; } __builtin_amdgcn_sched_barrier(0);
        float x18 = GDN_RHS(18); { const v4f l0 = GDN_L4(18, 0); const v4f l1 = GDN_L4(18, 1); const v4f l2 = GDN_L4(18, 2); const v4f l3 = GDN_L4(18, 3); const v4f l4 = GDN_L4(18, 4); __builtin_amdgcn_sched_barrier(0); x18 -= l0.x * x0; x18 -= l0.y * x1; x18 -= l0.z * x2; x18 -= l0.w * x3; x18 -= l1.x * x4; x18 -= l1.y * x5; x18 -= l1.z * x6; x18 -= l1.w * x7; x18 -= l2.x * x8; x18 -= l2.y * x9; x18 -= l2.z * x10; x18 -= l2.w * x11; x18 -= l3.x * x12; x18 -= l3.y * x13; x18 -= l3.z * x14; x18 -= l3.w * x15; x18 -= l4.x * x16; x18 -= l4.y * x17; } __builtin_amdgcn_sched_barrier(0);
        float x19 = GDN_RHS(19); { const v4f l0 = GDN_L4(19, 0); const v4f l1 = GDN_L4(19, 1); const v4f l2 = GDN_L4(19, 2); const v4f l3 = GDN_L4(19, 3); const v4f l4 = GDN_L4(19, 4); __builtin_amdgcn_sched_barrier(0); x19 -= l0.x * x0; x19 -= l0.y * x1; x19 -= l0.z * x2; x19 -= l0.w * x3; x19 -= l1.x * x4; x19 -= l1.y * x5; x19 -= l1.z * x6; x19 -= l1.w * x7; x19 -= l2.x * x8; x19 -= l2.y * x9; x19 -= l2.z * x10; x19 -= l2.w * x11; x19 -= l3.x * x12; x19 -= l3.y * x13; x19 -= l3.z * x14; x19 -= l3.w * x15; x19 -= l4.x * x16; x19 -= l4.y * x17; x19 -= l4.z * x18; } __builtin_amdgcn_sched_barrier(0);
        float x20 = GDN_RHS(20); { const v4f l0 = GDN_L4(20, 0); const v4f l1 = GDN_L4(20, 1); const v4f l2 = GDN_L4(20, 2); const v4f l3 = GDN_L4(20, 3); const v4f l4 = GDN_L4(20, 4); __builtin_amdgcn_sched_barrier(0); x20 -= l0.x * x0; x20 -= l0.y * x1; x20 -= l0.z * x2; x20 -= l0.w * x3; x20 -= l1.x * x4; x20 -= l1.y * x5; x20 -= l1.z * x6; x20 -= l1.w * x7; x20 -= l2.x * x8; x20 -= l2.y * x9; x20 -= l2.z * x10; x20 -= l2.w * x11; x20 -= l3.x * x12; x20 -= l3.y * x13; x20 -= l3.z * x14; x20 -= l3.w * x15; x20 -= l4.x * x16; x20 -= l4.y * x17; x20 -= l4.z * x18; x20 -= l4.w * x19; } __builtin_amdgcn_sched_barrier(0);
        float x21 = GDN_RHS(21); { const v4f l0 = GDN_L4(21, 0); const v4f l1 = GDN_L4(21, 1); const v4f l2 = GDN_L4(21, 2); const v4f l3 = GDN_L4(21, 3); const v4f l4 = GDN_L4(21, 4); const v4f l5 = GDN_L4(21, 5); __builtin_amdgcn_sched_barrier(0); x21 -= l0.x * x0; x21 -= l0.y * x1; x21 -= l0.z * x2; x21 -= l0.w * x3; x21 -= l1.x * x4; x21 -= l1.y * x5; x21 -= l1.z * x6; x21 -= l1.w * x7; x21 -= l2.x * x8; x21 -= l2.y * x9; x21 -= l2.z * x10; x21 -= l2.w * x11; x21 -= l3.x * x12; x21 -= l3.y * x13; x21 -= l3.z * x14; x21 -= l3.w * x15; x21 -= l4.x * x16; x21 -= l4.y * x17; x21 -= l4.z * x18; x21 -= l4.w * x19; x21 -= l5.x * x20; } __builtin_amdgcn_sched_barrier(0);
        float x22 = GDN_RHS(22); { const v4f l0 = GDN_L4(22, 0); const v4f l1 = GDN_L4(22, 1); const v4f l2 = GDN_L4(22, 2); const v4f l3 = GDN_L4(22, 3); const v4f l4 = GDN_L4(22, 4); const v4f l5 = GDN_L4(22, 5); __builtin_amdgcn_sched_barrier(0); x22 -= l0.x * x0; x22 -= l0.y * x1; x22 -= l0.z * x2; x22 -= l0.w * x3; x22 -= l1.x * x4; x22 -= l1.y * x5; x22 -= l1.z * x6; x22 -= l1.w * x7; x22 -= l2.x * x8; x22 -= l2.y * x9; x22 -= l2.z * x10; x22 -= l2.w * x11; x22 -= l3.x * x12; x22 -= l3.y * x13; x22 -= l3.z * x14; x22 -= l3.w * x15; x22 -= l4.x * x16; x22 -= l4.y * x17; x22 -= l4.z * x18; x22 -= l4.w * x19; x22 -= l5.x * x20; x22 -= l5.y * x21; } __builtin_amdgcn_sched_barrier(0);
        float x23 = GDN_RHS(23); { const v4f l0 = GDN_L4(23, 0); const v4f l1 = GDN_L4(23, 1); const v4f l2 = GDN_L4(23, 2); const v4f l3 = GDN_L4(23, 3); const v4f l4 = GDN_L4(23, 4); const v4f l5 = GDN_L4(23, 5); __builtin_amdgcn_sched_barrier(0); x23 -= l0.x * x0; x23 -= l0.y * x1; x23 -= l0.z * x2; x23 -= l0.w * x3; x23 -= l1.x * x4; x23 -= l1.y * x5; x23 -= l1.z * x6; x23 -= l1.w * x7; x23 -= l2.x * x8; x23 -= l2.y * x9; x23 -= l2.z * x10; x23 -= l2.w * x11; x23 -= l3.x * x12; x23 -= l3.y * x13; x23 -= l3.z * x14; x23 -= l3.w * x15; x23 -= l4.x * x16; x23 -= l4.y * x17; x23 -= l4.z * x18; x23 -= l4.w * x19; x23 -= l5.x * x20; x23 -= l5.y * x21; x23 -= l5.z * x22; } __builtin_amdgcn_sched_barrier(0);
        float x24 = GDN_RHS(24); { const v4f l0 = GDN_L4(24, 0); const v4f l1 = GDN_L4(24, 1); const v4f l2 = GDN_L4(24, 2); const v4f l3 = GDN_L4(24, 3); const v4f l4 = GDN_L4(24, 4); const v4f l5 = GDN_L4(24, 5); __builtin_amdgcn_sched_barrier(0); x24 -= l0.x * x0; x24 -= l0.y * x1; x24 -= l0.z * x2; x24 -= l0.w * x3; x24 -= l1.x * x4; x24 -= l1.y * x5; x24 -= l1.z * x6; x24 -= l1.w * x7; x24 -= l2.x * x8; x24 -= l2.y * x9; x24 -= l2.z * x10; x24 -= l2.w * x11; x24 -= l3.x * x12; x24 -= l3.y * x13; x24 -= l3.z * x14; x24 -= l3.w * x15; x24 -= l4.x * x16; x24 -= l4.y * x17; x24 -= l4.z * x18; x24 -= l4.w * x19; x24 -= l5.x * x20; x24 -= l5.y * x21; x24 -= l5.z * x22; x24 -= l5.w * x23; } __builtin_amdgcn_sched_barrier(0);
        float x25 = GDN_RHS(25); { const v4f l0 = GDN_L4(25, 0); const v4f l1 = GDN_L4(25, 1); const v4f l2 = GDN_L4(25, 2); const v4f l3 = GDN_L4(25, 3); const v4f l4 = GDN_L4(25, 4); const v4f l5 = GDN_L4(25, 5); __builtin_amdgcn_sched_barrier(0); x25 -= l0.x * x0; x25 -= l0.y * x1; x25 -= l0.z * x2; x25 -= l0.w * x3; x25 -= l1.x * x4; x25 -= l1.y * x5; x25 -= l1.z * x6; x25 -= l1.w * x7; x25 -= l2.x * x8; x25 -= l2.y * x9; x25 -= l2.z * x10; x25 -= l2.w * x11; x25 -= l3.x * x12; x25 -= l3.y * x13; x25 -= l3.z * x14; x25 -= l3.w * x15; x25 -= l4.x * x16; x25 -= l4.y * x17; x25 -= l4.z * x18; x25 -= l4.w * x19; x25 -= l5.x * x20; x25 -= l5.y * x21; x25 -= l5.z * x22; x25 -= l5.w * x23; } __builtin_amdgcn_sched_barrier(0); { const v4f l6 = GDN_L4(25, 6); __builtin_amdgcn_sched_barrier(0); x25 -= l6.x * x24; } __builtin_amdgcn_sched_barrier(0);
        float x26 = GDN_RHS(26); { const v4f l0 = GDN_L4(26, 0); const v4f l1 = GDN_L4(26, 1); const v4f l2 = GDN_L4(26, 2); const v4f l3 = GDN_L4(26, 3); const v4f l4 = GDN_L4(26, 4); const v4f l5 = GDN_L4(26, 5); __builtin_amdgcn_sched_barrier(0); x26 -= l0.x * x0; x26 -= l0.y * x1; x26 -= l0.z * x2; x26 -= l0.w * x3; x26 -= l1.x * x4; x26 -= l1.y * x5; x26 -= l1.z * x6; x26 -= l1.w * x7; x26 -= l2.x * x8; x26 -= l2.y * x9; x26 -= l2.z * x10; x26 -= l2.w * x11; x26 -= l3.x * x12; x26 -= l3.y * x13; x26 -= l3.z * x14; x26 -= l3.w * x15; x26 -= l4.x * x16; x26 -= l4.y * x17; x26 -= l4.z * x18; x26 -= l4.w * x19; x26 -= l5.x * x20; x26 -= l5.y * x21; x26 -= l5.z * x22; x26 -= l5.w * x23; } __builtin_amdgcn_sched_barrier(0); { const v4f l6 = GDN_L4(26, 6); __builtin_amdgcn_sched_barrier(0); x26 -= l6.x * x24; x26 -= l6.y * x25; } __builtin_amdgcn_sched_barrier(0);
        float x27 = GDN_RHS(27); { const v4f l0 = GDN_L4(27, 0); const v4f l1 = GDN_L4(27, 1); const v4f l2 = GDN_L4(27, 2); const v4f l3 = GDN_L4(27, 3); const v4f l4 = GDN_L4(27, 4); const v4f l5 = GDN_L4(27, 5); __builtin_amdgcn_sched_barrier(0); x27 -= l0.x * x0; x27 -= l0.y * x1; x27 -= l0.z * x2; x27 -= l0.w * x3; x27 -= l1.x * x4; x27 -= l1.y * x5; x27 -= l1.z * x6; x27 -= l1.w * x7; x27 -= l2.x * x8; x27 -= l2.y * x9; x27 -= l2.z * x10; x27 -= l2.w * x11; x27 -= l3.x * x12; x27 -= l3.y * x13; x27 -= l3.z * x14; x27 -= l3.w * x15; x27 -= l4.x * x16; x27 -= l4.y * x17; x27 -= l4.z * x18; x27 -= l4.w * x19; x27 -= l5.x * x20; x27 -= l5.y * x21; x27 -= l5.z * x22; x27 -= l5.w * x23; } __builtin_amdgcn_sched_barrier(0); { const v4f l6 = GDN_L4(27, 6); __builtin_amdgcn_sched_barrier(0); x27 -= l6.x * x24; x27 -= l6.y * x25; x27 -= l6.z * x26; } __builtin_amdgcn_sched_barrier(0);
        float x28 = GDN_RHS(28); { const v4f l0 = GDN_L4(28, 0); const v4f l1 = GDN_L4(28, 1); const v4f l2 = GDN_L4(28, 2); const v4f l3 = GDN_L4(28, 3); const v4f l4 = GDN_L4(28, 4); const v4f l5 = GDN_L4(28, 5); __builtin_amdgcn_sched_barrier(0); x28 -= l0.x * x0; x28 -= l0.y * x1; x28 -= l0.z * x2; x28 -= l0.w * x3; x28 -= l1.x * x4; x28 -= l1.y * x5; x28 -= l1.z * x6; x28 -= l1.w * x7; x28 -= l2.x * x8; x28 -= l2.y * x9; x28 -= l2.z * x10; x28 -= l2.w * x11; x28 -= l3.x * x12; x28 -= l3.y * x13; x28 -= l3.z * x14; x28 -= l3.w * x15; x28 -= l4.x * x16; x28 -= l4.y * x17; x28 -= l4.z * x18; x28 -= l4.w * x19; x28 -= l5.x * x20; x28 -= l5.y * x21; x28 -= l5.z * x22; x28 -= l5.w * x23; } __builtin_amdgcn_sched_barrier(0); { const v4f l6 = GDN_L4(28, 6); __builtin_amdgcn_sched_barrier(0); x28 -= l6.x * x24; x28 -= l6.y * x25; x28 -= l6.z * x26; x28 -= l6.w * x27; } __builtin_amdgcn_sched_barrier(0);
        float x29 = GDN_RHS(29); { const v4f l0 = GDN_L4(29, 0); const v4f l1 = GDN_L4(29, 1); const v4f l2 = GDN_L4(29, 2); const v4f l3 = GDN_L4(29, 3); const v4f l4 = GDN_L4(29, 4); const v4f l5 = GDN_L4(29, 5); __builtin_amdgcn_sched_barrier(0); x29 -= l0.x * x0; x29 -= l0.y * x1; x29 -= l0.z * x2; x29 -= l0.w * x3; x29 -= l1.x * x4; x29 -= l1.y * x5; x29 -= l1.z * x6; x29 -= l1.w * x7; x29 -= l2.x * x8; x29 -= l2.y * x9; x29 -= l2.z * x10; x29 -= l2.w * x11; x29 -= l3.x * x12; x29 -= l3.y * x13; x29 -= l3.z * x14; x29 -= l3.w * x15; x29 -= l4.x * x16; x29 -= l4.y * x17; x29 -= l4.z * x18; x29 -= l4.w * x19; x29 -= l5.x * x20; x29 -= l5.y * x21; x29 -= l5.z * x22; x29 -= l5.w * x23; } __builtin_amdgcn_sched_barrier(0); { const v4f l6 = GDN_L4(29, 6); const v4f l7 = GDN_L4(29, 7); __builtin_amdgcn_sched_barrier(0); x29 -= l6.x * x24; x29 -= l6.y * x25; x29 -= l6.z * x26; x29 -= l6.w * x27; x29 -= l7.x * x28; } __builtin_amdgcn_sched_barrier(0);
        float x30 = GDN_RHS(30); { const v4f l0 = GDN_L4(30, 0); const v4f l1 = GDN_L4(30, 1); const v4f l2 = GDN_L4(30, 2); const v4f l3 = GDN_L4(30, 3); const v4f l4 = GDN_L4(30, 4); const v4f l5 = GDN_L4(30, 5); __builtin_amdgcn_sched_barrier(0); x30 -= l0.x * x0; x30 -= l0.y * x1; x30 -= l0.z * x2; x30 -= l0.w * x3; x30 -= l1.x * x4; x30 -= l1.y * x5; x30 -= l1.z * x6; x30 -= l1.w * x7; x30 -= l2.x * x8; x30 -= l2.y * x9; x30 -= l2.z * x10; x30 -= l2.w * x11; x30 -= l3.x * x12; x30 -= l3.y * x13; x30 -= l3.z * x14; x30 -= l3.w * x15; x30 -= l4.x * x16; x30 -= l4.y * x17; x30 -= l4.z * x18; x30 -= l4.w * x19; x30 -= l5.x * x20; x30 -= l5.y * x21; x30 -= l5.z * x22; x30 -= l5.w * x23; } __builtin_amdgcn_sched_barrier(0); { const v4f l6 = GDN_L4(30, 6); const v4f l7 = GDN_L4(30, 7); __builtin_amdgcn_sched_barrier(0); x30 -= l6.x * x24; x30 -= l6.y * x25; x30 -= l6.z * x26; x30 -= l6.w * x27; x30 -= l7.x * x28; x30 -= l7.y * x29; } __builtin_amdgcn_sched_barrier(0);
        float x31 = GDN_RHS(31); { const v4f l0 = GDN_L4(31, 0); const v4f l1 = GDN_L4(31, 1); const v4f l2 = GDN_L4(31, 2); const v4f l3 = GDN_L4(31, 3); const v4f l4 = GDN_L4(31, 4); const v4f l5 = GDN_L4(31, 5); __builtin_amdgcn_sched_barrier(0); x31 -= l0.x * x0; x31 -= l0.y * x1; x31 -= l0.z * x2; x31 -= l0.w * x3; x31 -= l1.x * x4; x31 -= l1.y * x5; x31 -= l1.z * x6; x31 -= l1.w * x7; x31 -= l2.x * x8; x31 -= l2.y * x9; x31 -= l2.z * x10; x31 -= l2.w * x11; x31 -= l3.x * x12; x31 -= l3.y * x13; x31 -= l3.z * x14; x31 -= l3.w * x15; x31 -= l4.x * x16; x31 -= l4.y * x17; x31 -= l4.z * x18; x31 -= l4.w * x19; x31 -= l5.x * x20; x31 -= l5.y * x21; x31 -= l5.z * x22; x31 -= l5.w * x23; } __builtin_amdgcn_sched_barrier(0); { const v4f l6 = GDN_L4(31, 6); const v4f l7 = GDN_L4(31, 7); __builtin_amdgcn_sched_barrier(0); x31 -= l6.x * x24; x31 -= l6.y * x25; x31 -= l6.z * x26; x31 -= l6.w * x27; x31 -= l7.x * x28; x31 -= l7.y * x29; x31 -= l7.z * x30; } __builtin_amdgcn_sched_barrier(0);
        float x32 = GDN_RHS(32); { const v4f l0 = GDN_L4(32, 0); const v4f l1 = GDN_L4(32, 1); const v4f l2 = GDN_L4(32, 2); const v4f l3 = GDN_L4(32, 3); const v4f l4 = GDN_L4(32, 4); const v4f l5 = GDN_L4(32, 5); __builtin_amdgcn_sched_barrier(0); x32 -= l0.x * x0; x32 -= l0.y * x1; x32 -= l0.z * x2; x32 -= l0.w * x3; x32 -= l1.x * x4; x32 -= l1.y * x5; x32 -= l1.z * x6; x32 -= l1.w * x7; x32 -= l2.x * x8; x32 -= l2.y * x9; x32 -= l2.z * x10; x32 -= l2.w * x11; x32 -= l3.x * x12; x32 -= l3.y * x13; x32 -= l3.z * x14; x32 -= l3.w * x15; x32 -= l4.x * x16; x32 -= l4.y * x17; x32 -= l4.z * x18; x32 -= l4.w * x19; x32 -= l5.x * x20; x32 -= l5.y * x21; x32 -= l5.z * x22; x32 -= l5.w * x23; } __builtin_amdgcn_sched_barrier(0); { const v4f l6 = GDN_L4(32, 6); const v4f l7 = GDN_L4(32, 7); __builtin_amdgcn_sched_barrier(0); x32 -= l6.x * x24; x32 -= l6.y * x25; x32 -= l6.z * x26; x32 -= l6.w * x27; x32 -= l7.x * x28; x32 -= l7.y * x29; x32 -= l7.z * x30; x32 -= l7.w * x31; } __builtin_amdgcn_sched_barrier(0);
        float x33 = GDN_RHS(33); { const v4f l0 = GDN_L4(33, 0); const v4f l1 = GDN_L4(33, 1); const v4f l2 = GDN_L4(33, 2); const v4f l3 = GDN_L4(33, 3); const v4f l4 = GDN_L4(33, 4); const v4f l5 = GDN_L4(33, 5); __builtin_amdgcn_sched_barrier(0); x33 -= l0.x * x0; x33 -= l0.y * x1; x33 -= l0.z * x2; x33 -= l0.w * x3; x33 -= l1.x * x4; x33 -= l1.y * x5; x33 -= l1.z * x6; x33 -= l1.w * x7; x33 -= l2.x * x8; x33 -= l2.y * x9; x33 -= l2.z * x10; x33 -= l2.w * x11; x33 -= l3.x * x12; x33 -= l3.y * x13; x33 -= l3.z * x14; x33 -= l3.w * x15; x33 -= l4.x * x16; x33 -= l4.y * x17; x33 -= l4.z * x18; x33 -= l4.w * x19; x33 -= l5.x * x20; x33 -= l5.y * x21; x33 -= l5.z * x22; x33 -= l5.w * x23; } __builtin_amdgcn_sched_barrier(0); { const v4f l6 = GDN_L4(33, 6); const v4f l7 = GDN_L4(33, 7); const v4f l8 = GDN_L4(33, 8); __builtin_amdgcn_sched_barrier(0); x33 -= l6.x * x24; x33 -= l6.y * x25; x33 -= l6.z * x26; x33 -= l6.w * x27; x33 -= l7.x * x28; x33 -= l7.y * x29; x33 -= l7.z * x30; x33 -= l7.w * x31; x33 -= l8.x * x32; } __builtin_amdgcn_sched_barrier(0);
        float x34 = GDN_RHS(34); { const v4f l0 = GDN_L4(34, 0); const v4f l1 = GDN_L4(34, 1); const v4f l2 = GDN_L4(34, 2); const v4f l3 = GDN_L4(34, 3); const v4f l4 = GDN_L4(34, 4); const v4f l5 = GDN_L4(34, 5); __builtin_amdgcn_sched_barrier(0); x34 -= l0.x * x0; x34 -= l0.y * x1; x34 -= l0.z * x2; x34 -= l0.w * x3; x34 -= l1.x * x4; x34 -= l1.y * x5; x34 -= l1.z * x6; x34 -= l1.w * x7; x34 -= l2.x * x8; x34 -= l2.y * x9; x34 -= l2.z * x10; x34 -= l2.w * x11; x34 -= l3.x * x12; x34 -= l3.y * x13; x34 -= l3.z * x14; x34 -= l3.w * x15; x34 -= l4.x * x16; x34 -= l4.y * x17; x34 -= l4.z * x18; x34 -= l4.w * x19; x34 -= l5.x * x20; x34 -= l5.y * x21; x34 -= l5.z * x22; x34 -= l5.w * x23; } __builtin_amdgcn_sched_barrier(0); { const v4f l6 = GDN_L4(34, 6); const v4f l7 = GDN_L4(34, 7); const v4f l8 = GDN_L4(34, 8); __builtin_amdgcn_sched_barrier(0); x34 -= l6.x * x24; x34 -= l6.y * x25; x34 -= l6.z * x26; x34 -= l6.w * x27; x34 -= l7.x * x28; x34 -= l7.y * x29; x34 -= l7.z * x30; x34 -= l7.w * x31; x34 -= l8.x * x32; x34 -= l8.y * x33; } __builtin_amdgcn_sched_barrier(0);
        float x35 = GDN_RHS(35); { const v4f l0 = GDN_L4(35, 0); const v4f l1 = GDN_L4(35, 1); const v4f l2 = GDN_L4(35, 2); const v4f l3 = GDN_L4(35, 3); const v4f l4 = GDN_L4(35, 4); const v4f l5 = GDN_L4(35, 5); __builtin_amdgcn_sched_barrier(0); x35 -= l0.x * x0; x35 -= l0.y * x1; x35 -= l0.z * x2; x35 -= l0.w * x3; x35 -= l1.x * x4; x35 -= l1.y * x5; x35 -= l1.z * x6; x35 -= l1.w * x7; x35 -= l2.x * x8; x35 -= l2.y * x9; x35 -= l2.z * x10; x35 -= l2.w * x11; x35 -= l3.x * x12; x35 -= l3.y * x13; x35 -= l3.z * x14; x35 -= l3.w * x15; x35 -= l4.x * x16; x35 -= l4.y * x17; x35 -= l4.z * x18; x35 -= l4.w * x19; x35 -= l5.x * x20; x35 -= l5.y * x21; x35 -= l5.z * x22; x35 -= l5.w * x23; } __builtin_amdgcn_sched_barrier(0); { const v4f l6 = GDN_L4(35, 6); const v4f l7 = GDN_L4(35, 7); const v4f l8 = GDN_L4(35, 8); __builtin_amdgcn_sched_barrier(0); x35 -= l6.x * x24; x35 -= l6.y * x25; x35 -= l6.z * x26; x35 -= l6.w * x27; x35 -= l7.x * x28; x35 -= l7.y * x29; x35 -= l7.z * x30; x35 -= l7.w * x31; x35 -= l8.x * x32; x35 -= l8.y * x33; x35 -= l8.z * x34; } __builtin_amdgcn_sched_barrier(0);
        float x36 = GDN_RHS(36); { const v4f l0 = GDN_L4(36, 0); const v4f l1 = GDN_L4(36, 1); const v4f l2 = GDN_L4(36, 2); const v4f l3 = GDN_L4(36, 3); const v4f l4 = GDN_L4(36, 4); const v4f l5 = GDN_L4(36, 5); __builtin_amdgcn_sched_barrier(0); x36 -= l0.x * x0; x36 -= l0.y * x1; x36 -= l0.z * x2; x36 -= l0.w * x3; x36 -= l1.x * x4; x36 -= l1.y * x5; x36 -= l1.z * x6; x36 -= l1.w * x7; x36 -= l2.x * x8; x36 -= l2.y * x9; x36 -= l2.z * x10; x36 -= l2.w * x11; x36 -= l3.x * x12; x36 -= l3.y * x13; x36 -= l3.z * x14; x36 -= l3.w * x15; x36 -= l4.x * x16; x36 -= l4.y * x17; x36 -= l4.z * x18; x36 -= l4.w * x19; x36 -= l5.x * x20; x36 -= l5.y * x21; x36 -= l5.z * x22; x36 -= l5.w * x23; } __builtin_amdgcn_sched_barrier(0); { const v4f l6 = GDN_L4(36, 6); const v4f l7 = GDN_L4(36, 7); const v4f l8 = GDN_L4(36, 8); __builtin_amdgcn_sched_barrier(0); x36 -= l6.x * x24; x36 -= l6.y * x25; x36 -= l6.z * x26; x36 -= l6.w * x27; x36 -= l7.x * x28; x36 -= l7.y * x29; x36 -= l7.z * x30; x36 -= l7.w * x31; x36 -= l8.x * x32; x36 -= l8.y * x33; x36 -= l8.z * x34; x36 -= l8.w * x35; } __builtin_amdgcn_sched_barrier(0);
        float x37 = GDN_RHS(37); { const v4f l0 = GDN_L4(37, 0); const v4f l1 = GDN_L4(37, 1); const v4f l2 = GDN_L4(37, 2); const v4f l3 = GDN_L4(37, 3); const v4f l4 = GDN_L4(37, 4); const v4f l5 = GDN_L4(37, 5); __builtin_amdgcn_sched_barrier(0); x37 -= l0.x * x0; x37 -= l0.y * x1; x37 -= l0.z * x2; x37 -= l0.w * x3; x37 -= l1.x * x4; x37 -= l1.y * x5; x37 -= l1.z * x6; x37 -= l1.w * x7; x37 -= l2.x * x8; x37 -= l2.y * x9; x37 -= l2.z * x10; x37 -= l2.w * x11; x37 -= l3.x * x12; x37 -= l3.y * x13; x37 -= l3.z * x14; x37 -= l3.w * x15; x37 -= l4.x * x16; x37 -= l4.y * x17; x37 -= l4.z * x18; x37 -= l4.w * x19; x37 -= l5.x * x20; x37 -= l5.y * x21; x37 -= l5.z * x22; x37 -= l5.w * x23; } __builtin_amdgcn_sched_barrier(0); { const v4f l6 = GDN_L4(37, 6); const v4f l7 = GDN_L4(37, 7); const v4f l8 = GDN_L4(37, 8); const v4f l9 = GDN_L4(37, 9); __builtin_amdgcn_sched_barrier(0); x37 -= l6.x * x24; x37 -= l6.y * x25; x37 -= l6.z * x26; x37 -= l6.w * x27; x37 -= l7.x * x28; x37 -= l7.y * x29; x37 -= l7.z * x30; x37 -= l7.w * x31; x37 -= l8.x * x32; x37 -= l8.y * x33; x37 -= l8.z * x34; x37 -= l8.w * x35; x37 -= l9.x * x36; } __builtin_amdgcn_sched_barrier(0);
        float x38 = GDN_RHS(38); { const v4f l0 = GDN_L4(38, 0); const v4f l1 = GDN_L4(38, 1); const v4f l2 = GDN_L4(38, 2); const v4f l3 = GDN_L4(38, 3); const v4f l4 = GDN_L4(38, 4); const v4f l5 = GDN_L4(38, 5); __builtin_amdgcn_sched_barrier(0); x38 -= l0.x * x0; x38 -= l0.y * x1; x38 -= l0.z * x2; x38 -= l0.w * x3; x38 -= l1.x * x4; x38 -= l1.y * x5; x38 -= l1.z * x6; x38 -= l1.w * x7; x38 -= l2.x * x8; x38 -= l2.y * x9; x38 -= l2.z * x10; x38 -= l2.w * x11; x38 -= l3.x * x12; x38 -= l3.y * x13; x38 -= l3.z * x14; x38 -= l3.w * x15; x38 -= l4.x * x16; x38 -= l4.y * x17; x38 -= l4.z * x18; x38 -= l4.w * x19; x38 -= l5.x * x20; x38 -= l5.y * x21; x38 -= l5.z * x22; x38 -= l5.w * x23; } __builtin_amdgcn_sched_barrier(0); { const v4f l6 = GDN_L4(38, 6); const v4f l7 = GDN_L4(38, 7); const v4f l8 = GDN_L4(38, 8); const v4f l9 = GDN_L4(38, 9); __builtin_amdgcn_sched_barrier(0); x38 -= l6.x * x24; x38 -= l6.y * x25; x38 -= l6.z * x26; x38 -= l6.w * x27; x38 -= l7.x * x28; x38 -= l7.y * x29; x38 -= l7.z * x30; x38 -= l7.w * x31; x38 -= l8.x * x32; x38 -= l8.y * x33; x38 -= l8.z * x34; x38 -= l8.w * x35; x38 -= l9.x * x36; x38 -= l9.y * x37; } __builtin_amdgcn_sched_barrier(0);
        float x39 = GDN_RHS(39); { const v4f l0 = GDN_L4(39, 0); const v4f l1 = GDN_L4(39, 1); const v4f l2 = GDN_L4(39, 2); const v4f l3 = GDN_L4(39, 3); const v4f l4 = GDN_L4(39, 4); const v4f l5 = GDN_L4(39, 5); __builtin_amdgcn_sched_barrier(0); x39 -= l0.x * x0; x39 -= l0.y * x1; x39 -= l0.z * x2; x39 -= l0.w * x3; x39 -= l1.x * x4; x39 -= l1.y * x5; x39 -= l1.z * x6; x39 -= l1.w * x7; x39 -= l2.x * x8; x39 -= l2.y * x9; x39 -= l2.z * x10; x39 -= l2.w * x11; x39 -= l3.x * x12; x39 -= l3.y * x13; x39 -= l3.z * x14; x39 -= l3.w * x15; x39 -= l4.x * x16; x39 -= l4.y * x17; x39 -= l4.z * x18; x39 -= l4.w * x19; x39 -= l5.x * x20; x39 -= l5.y * x21; x39 -= l5.z * x22; x39 -= l5.w * x23; } __builtin_amdgcn_sched_barrier(0); { const v4f l6 = GDN_L4(39, 6); const v4f l7 = GDN_L4(39, 7); const v4f l8 = GDN_L4(39, 8); const v4f l9 = GDN_L4(39, 9); __builtin_amdgcn_sched_barrier(0); x39 -= l6.x * x24; x39 -= l6.y * x25; x39 -= l6.z * x26; x39 -= l6.w * x27; x39 -= l7.x * x28; x39 -= l7.y * x29; x39 -= l7.z * x30; x39 -= l7.w * x31; x39 -= l8.x * x32; x39 -= l8.y * x33; x39 -= l8.z * x34; x39 -= l8.w * x35; x39 -= l9.x * x36; x39 -= l9.y * x37; x39 -= l9.z * x38; } __builtin_amdgcn_sched_barrier(0);
        float x40 = GDN_RHS(40); { const v4f l0 = GDN_L4(40, 0); const v4f l1 = GDN_L4(40, 1); const v4f l2 = GDN_L4(40, 2); const v4f l3 = GDN_L4(40, 3); const v4f l4 = GDN_L4(40, 4); const v4f l5 = GDN_L4(40, 5); __builtin_amdgcn_sched_barrier(0); x40 -= l0.x * x0; x40 -= l0.y * x1; x40 -= l0.z * x2; x40 -= l0.w * x3; x40 -= l1.x * x4; x40 -= l1.y * x5; x40 -= l1.z * x6; x40 -= l1.w * x7; x40 -= l2.x * x8; x40 -= l2.y * x9; x40 -= l2.z * x10; x40 -= l2.w * x11; x40 -= l3.x * x12; x40 -= l3.y * x13; x40 -= l3.z * x14; x40 -= l3.w * x15; x40 -= l4.x * x16; x40 -= l4.y * x17; x40 -= l4.z * x18; x40 -= l4.w * x19; x40 -= l5.x * x20; x40 -= l5.y * x21; x40 -= l5.z * x22; x40 -= l5.w * x23; } __builtin_amdgcn_sched_barrier(0); { const v4f l6 = GDN_L4(40, 6); const v4f l7 = GDN_L4(40, 7); const v4f l8 = GDN_L4(40, 8); const v4f l9 = GDN_L4(40, 9); __builtin_amdgcn_sched_barrier(0); x40 -= l6.x * x24; x40 -= l6.y * x25; x40 -= l6.z * x26; x40 -= l6.w * x27; x40 -= l7.x * x28; x40 -= l7.y * x29; x40 -= l7.z * x30; x40 -= l7.w * x31; x40 -= l8.x * x32; x40 -= l8.y * x33; x40 -= l8.z * x34; x40 -= l8.w * x35; x40 -= l9.x * x36; x40 -= l9.y * x37; x40 -= l9.z * x38; x40 -= l9.w * x39; } __builtin_amdgcn_sched_barrier(0);
        float x41 = GDN_RHS(41); { const v4f l0 = GDN_L4(41, 0); const v4f l1 = GDN_L4(41, 1); const v4f l2 = GDN_L4(41, 2); const v4f l3 = GDN_L4(41, 3); const v4f l4 = GDN_L4(41, 4); const v4f l5 = GDN_L4(41, 5); __builtin_amdgcn_sched_barrier(0); x41 -= l0.x * x0; x41 -= l0.y * x1; x41 -= l0.z * x2; x41 -= l0.w * x3; x41 -= l1.x * x4; x41 -= l1.y * x5; x41 -= l1.z * x6; x41 -= l1.w * x7; x41 -= l2.x * x8; x41 -= l2.y * x9; x41 -= l2.z * x10; x41 -= l2.w * x11; x41 -= l3.x * x12; x41 -= l3.y * x13; x41 -= l3.z * x14; x41 -= l3.w * x15; x41 -= l4.x * x16; x41 -= l4.y * x17; x41 -= l4.z * x18; x41 -= l4.w * x19; x41 -= l5.x * x20; x41 -= l5.y * x21; x41 -= l5.z * x22; x41 -= l5.w * x23; } __builtin_amdgcn_sched_barrier(0); { const v4f l6 = GDN_L4(41, 6); const v4f l7 = GDN_L4(41, 7); const v4f l8 = GDN_L4(41, 8); const v4f l9 = GDN_L4(41, 9); const v4f l10 = GDN_L4(41, 10); __builtin_amdgcn_sched_barrier(0); x41 -= l6.x * x24; x41 -= l6.y * x25; x41 -= l6.z * x26; x41 -= l6.w * x27; x41 -= l7.x * x28; x41 -= l7.y * x29; x41 -= l7.z * x30; x41 -= l7.w * x31; x41 -= l8.x * x32; x41 -= l8.y * x33; x41 -= l8.z * x34; x41 -= l8.w * x35; x41 -= l9.x * x36; x41 -= l9.y * x37; x41 -= l9.z * x38; x41 -= l9.w * x39; x41 -= l10.x * x40; } __builtin_amdgcn_sched_barrier(0);
        float x42 = GDN_RHS(42); { const v4f l0 = GDN_L4(42, 0); const v4f l1 = GDN_L4(42, 1); const v4f l2 = GDN_L4(42, 2); const v4f l3 = GDN_L4(42, 3); const v4f l4 = GDN_L4(42, 4); const v4f l5 = GDN_L4(42, 5); __builtin_amdgcn_sched_barrier(0); x42 -= l0.x * x0; x42 -= l0.y * x1; x42 -= l0.z * x2; x42 -= l0.w * x3; x42 -= l1.x * x4; x42 -= l1.y * x5; x42 -= l1.z * x6; x42 -= l1.w * x7; x42 -= l2.x * x8; x42 -= l2.y * x9; x42 -= l2.z * x10; x42 -= l2.w * x11; x42 -= l3.x * x12; x42 -= l3.y * x13; x42 -= l3.z * x14; x42 -= l3.w * x15; x42 -= l4.x * x16; x42 -= l4.y * x17; x42 -= l4.z * x18; x42 -= l4.w * x19; x42 -= l5.x * x20; x42 -= l5.y * x21; x42 -= l5.z * x22; x42 -= l5.w * x23; } __builtin_amdgcn_sched_barrier(0); { const v4f l6 = GDN_L4(42, 6); const v4f l7 = GDN_L4(42, 7); const v4f l8 = GDN_L4(42, 8); const v4f l9 = GDN_L4(42, 9); const v4f l10 = GDN_L4(42, 10); __builtin_amdgcn_sched_barrier(0); x42 -= l6.x * x24; x42 -= l6.y * x25; x42 -= l6.z * x26; x42 -= l6.w * x27; x42 -= l7.x * x28; x42 -= l7.y * x29; x42 -= l7.z * x30; x42 -= l7.w * x31; x42 -= l8.x * x32; x42 -= l8.y * x33; x42 -= l8.z * x34; x42 -= l8.w * x35; x42 -= l9.x * x36; x42 -= l9.y * x37; x42 -= l9.z * x38; x42 -= l9.w * x39; x42 -= l10.x * x40; x42 -= l10.y * x41; } __builtin_amdgcn_sched_barrier(0);
        float x43 = GDN_RHS(43); { const v4f l0 = GDN_L4(43, 0); const v4f l1 = GDN_L4(43, 1); const v4f l2 = GDN_L4(43, 2); const v4f l3 = GDN_L4(43, 3); const v4f l4 = GDN_L4(43, 4); const v4f l5 = GDN_L4(43, 5); __builtin_amdgcn_sched_barrier(0); x43 -= l0.x * x0; x43 -= l0.y * x1; x43 -= l0.z * x2; x43 -= l0.w * x3; x43 -= l1.x * x4; x43 -= l1.y * x5; x43 -= l1.z * x6; x43 -= l1.w * x7; x43 -= l2.x * x8; x43 -= l2.y * x9; x43 -= l2.z * x10; x43 -= l2.w * x11; x43 -= l3.x * x12; x43 -= l3.y * x13; x43 -= l3.z * x14; x43 -= l3.w * x15; x43 -= l4.x * x16; x43 -= l4.y * x17; x43 -= l4.z * x18; x43 -= l4.w * x19; x43 -= l5.x * x20; x43 -= l5.y * x21; x43 -= l5.z * x22; x43 -= l5.w * x23; } __builtin_amdgcn_sched_barrier(0); { const v4f l6 = GDN_L4(43, 6); const v4f l7 = GDN_L4(43, 7); const v4f l8 = GDN_L4(43, 8); const v4f l9 = GDN_L4(43, 9); const v4f l10 = GDN_L4(43, 10); __builtin_amdgcn_sched_barrier(0); x43 -= l6.x * x24; x43 -= l6.y * x25; x43 -= l6.z * x26; x43 -= l6.w * x27; x43 -= l7.x * x28; x43 -= l7.y * x29; x43 -= l7.z * x30; x43 -= l7.w * x31; x43 -= l8.x * x32; x43 -= l8.y * x33; x43 -= l8.z * x34; x43 -= l8.w * x35; x43 -= l9.x * x36; x43 -= l9.y * x37; x43 -= l9.z * x38; x43 -= l9.w * x39; x43 -= l10.x * x40; x43 -= l10.y * x41; x43 -= l10.z * x42; } __builtin_amdgcn_sched_barrier(0);
        float x44 = GDN_RHS(44); { const v4f l0 = GDN_L4(44, 0); const v4f l1 = GDN_L4(44, 1); const v4f l2 = GDN_L4(44, 2); const v4f l3 = GDN_L4(44, 3); const v4f l4 = GDN_L4(44, 4); const v4f l5 = GDN_L4(44, 5); __builtin_amdgcn_sched_barrier(0); x44 -= l0.x * x0; x44 -= l0.y * x1; x44 -= l0.z * x2; x44 -= l0.w * x3; x44 -= l1.x * x4; x44 -= l1.y * x5; x44 -= l1.z * x6; x44 -= l1.w * x7; x44 -= l2.x * x8; x44 -= l2.y * x9; x44 -= l2.z * x10; x44 -= l2.w * x11; x44 -= l3.x * x12; x44 -= l3.y * x13; x44 -= l3.z * x14; x44 -= l3.w * x15; x44 -= l4.x * x16; x44 -= l4.y * x17; x44 -= l4.z * x18; x44 -= l4.w * x19; x44 -= l5.x * x20; x44 -= l5.y * x21; x44 -= l5.z * x22; x44 -= l5.w * x23; } __builtin_amdgcn_sched_barrier(0); { const v4f l6 = GDN_L4(44, 6); const v4f l7 = GDN_L4(44, 7); const v4f l8 = GDN_L4(44, 8); const v4f l9 = GDN_L4(44, 9); const v4f l10 = GDN_L4(44, 10); __builtin_amdgcn_sched_barrier(0); x44 -= l6.x * x24; x44 -= l6.y * x25; x44 -= l6.z * x26; x44 -= l6.w * x27; x44 -= l7.x * x28; x44 -= l7.y * x29; x44 -= l7.z * x30; x44 -= l7.w * x31; x44 -= l8.x * x32; x44 -= l8.y * x33; x44 -= l8.z * x34; x44 -= l8.w * x35; x44 -= l9.x * x36; x44 -= l9.y * x37; x44 -= l9.z * x38; x44 -= l9.w * x39; x44 -= l10.x * x40; x44 -= l10.y * x41; x44 -= l10.z * x42; x44 -= l10.w * x43; } __builtin_amdgcn_sched_barrier(0);
        float x45 = GDN_RHS(45); { const v4f l0 = GDN_L4(45, 0); const v4f l1 = GDN_L4(45, 1); const v4f l2 = GDN_L4(45, 2); const v4f l3 = GDN_L4(45, 3); const v4f l4 = GDN_L4(45, 4); const v4f l5 = GDN_L4(45, 5); __builtin_amdgcn_sched_barrier(0); x45 -= l0.x * x0; x45 -= l0.y * x1; x45 -= l0.z * x2; x45 -= l0.w * x3; x45 -= l1.x * x4; x45 -= l1.y * x5; x45 -= l1.z * x6; x45 -= l1.w * x7; x45 -= l2.x * x8; x45 -= l2.y * x9; x45 -= l2.z * x10; x45 -= l2.w * x11; x45 -= l3.x * x12; x45 -= l3.y * x13; x45 -= l3.z * x14; x45 -= l3.w * x15; x45 -= l4.x * x16; x45 -= l4.y * x17; x45 -= l4.z * x18; x45 -= l4.w * x19; x45 -= l5.x * x20; x45 -= l5.y * x21; x45 -= l5.z * x22; x45 -= l5.w * x23; } __builtin_amdgcn_sched_barrier(0); { const v4f l6 = GDN_L4(45, 6); const v4f l7 = GDN_L4(45, 7); const v4f l8 = GDN_L4(45, 8); const v4f l9 = GDN_L4(45, 9); const v4f l10 = GDN_L4(45, 10); const v4f l11 = GDN_L4(45, 11); __builtin_amdgcn_sched_barrier(0); x45 -= l6.x * x24; x45 -= l6.y * x25; x45 -= l6.z * x26; x45 -= l6.w * x27; x45 -= l7.x * x28; x45 -= l7.y * x29; x45 -= l7.z * x30; x45 -= l7.w * x31; x45 -= l8.x * x32; x45 -= l8.y * x33; x45 -= l8.z * x34; x45 -= l8.w * x35; x45 -= l9.x * x36; x45 -= l9.y * x37; x45 -= l9.z * x38; x45 -= l9.w * x39; x45 -= l10.x * x40; x45 -= l10.y * x41; x45 -= l10.z * x42; x45 -= l10.w * x43; x45 -= l11.x * x44; } __builtin_amdgcn_sched_barrier(0);
        float x46 = GDN_RHS(46); { const v4f l0 = GDN_L4(46, 0); const v4f l1 = GDN_L4(46, 1); const v4f l2 = GDN_L4(46, 2); const v4f l3 = GDN_L4(46, 3); const v4f l4 = GDN_L4(46, 4); const v4f l5 = GDN_L4(46, 5); __builtin_amdgcn_sched_barrier(0); x46 -= l0.x * x0; x46 -= l0.y * x1; x46 -= l0.z * x2; x46 -= l0.w * x3; x46 -= l1.x * x4; x46 -= l1.y * x5; x46 -= l1.z * x6; x46 -= l1.w * x7; x46 -= l2.x * x8; x46 -= l2.y * x9; x46 -= l2.z * x10; x46 -= l2.w * x11; x46 -= l3.x * x12; x46 -= l3.y * x13; x46 -= l3.z * x14; x46 -= l3.w * x15; x46 -= l4.x * x16; x46 -= l4.y * x17; x46 -= l4.z * x18; x46 -= l4.w * x19; x46 -= l5.x * x20; x46 -= l5.y * x21; x46 -= l5.z * x22; x46 -= l5.w * x23; } __builtin_amdgcn_sched_barrier(0); { const v4f l6 = GDN_L4(46, 6); const v4f l7 = GDN_L4(46, 7); const v4f l8 = GDN_L4(46, 8); const v4f l9 = GDN_L4(46, 9); const v4f l10 = GDN_L4(46, 10); const v4f l11 = GDN_L4(46, 11); __builtin_amdgcn_sched_barrier(0); x46 -= l6.x * x24; x46 -= l6.y * x25; x46 -= l6.z * x26; x46 -= l6.w * x27; x46 -= l7.x * x28; x46 -= l7.y * x29; x46 -= l7.z * x30; x46 -= l7.w * x31; x46 -= l8.x * x32; x46 -= l8.y * x33; x46 -= l8.z * x34; x46 -= l8.w * x35; x46 -= l9.x * x36; x46 -= l9.y * x37; x46 -= l9.z * x38; x46 -= l9.w * x39; x46 -= l10.x * x40; x46 -= l10.y * x41; x46 -= l10.z * x42; x46 -= l10.w * x43; x46 -= l11.x * x44; x46 -= l11.y * x45; } __builtin_amdgcn_sched_barrier(0);
        float x47 = GDN_RHS(47); { const v4f l0 = GDN_L4(47, 0); const v4f l1 = GDN_L4(47, 1); const v4f l2 = GDN_L4(47, 2); const v4f l3 = GDN_L4(47, 3); const v4f l4 = GDN_L4(47, 4); const v4f l5 = GDN_L4(47, 5); __builtin_amdgcn_sched_barrier(0); x47 -= l0.x * x0; x47 -= l0.y * x1; x47 -= l0.z * x2; x47 -= l0.w * x3; x47 -= l1.x * x4; x47 -= l1.y * x5; x47 -= l1.z * x6; x47 -= l1.w * x7; x47 -= l2.x * x8; x47 -= l2.y * x9; x47 -= l2.z * x10; x47 -= l2.w * x11; x47 -= l3.x * x12; x47 -= l3.y * x13; x47 -= l3.z * x14; x47 -= l3.w * x15; x47 -= l4.x * x16; x47 -= l4.y * x17; x47 -= l4.z * x18; x47 -= l4.w * x19; x47 -= l5.x * x20; x47 -= l5.y * x21; x47 -= l5.z * x22; x47 -= l5.w * x23; } __builtin_amdgcn_sched_barrier(0); { const v4f l6 = GDN_L4(47, 6); const v4f l7 = GDN_L4(47, 7); const v4f l8 = GDN_L4(47, 8); const v4f l9 = GDN_L4(47, 9); const v4f l10 = GDN_L4(47, 10); const v4f l11 = GDN_L4(47, 11); __builtin_amdgcn_sched_barrier(0); x47 -= l6.x * x24; x47 -= l6.y * x25; x47 -= l6.z * x26; x47 -= l6.w * x27; x47 -= l7.x * x28; x47 -= l7.y * x29; x47 -= l7.z * x30; x47 -= l7.w * x31; x47 -= l8.x * x32; x47 -= l8.y * x33; x47 -= l8.z * x34; x47 -= l8.w * x35; x47 -= l9.x * x36; x47 -= l9.y * x37; x47 -= l9.z * x38; x47 -= l9.w * x39; x47 -= l10.x * x40; x47 -= l10.y * x41; x47 -= l10.z * x42; x47 -= l10.w * x43; x47 -= l11.x * x44; x47 -= l11.y * x45; x47 -= l11.z * x46; } __builtin_amdgcn_sched_barrier(0);
        float x48 = GDN_RHS(48); { const v4f l0 = GDN_L4(48, 0); const v4f l1 = GDN_L4(48, 1); const v4f l2 = GDN_L4(48, 2); const v4f l3 = GDN_L4(48, 3); const v4f l4 = GDN_L4(48, 4); const v4f l5 = GDN_L4(48, 5); __builtin_amdgcn_sched_barrier(0); x48 -= l0.x * x0; x48 -= l0.y * x1; x48 -= l0.z * x2; x48 -= l0.w * x3; x48 -= l1.x * x4; x48 -= l1.y * x5; x48 -= l1.z * x6; x48 -= l1.w * x7; x48 -= l2.x * x8; x48 -= l2.y * x9; x48 -= l2.z * x10; x48 -= l2.w * x11; x48 -= l3.x * x12; x48 -= l3.y * x13; x48 -= l3.z * x14; x48 -= l3.w * x15; x48 -= l4.x * x16; x48 -= l4.y * x17; x48 -= l4.z * x18; x48 -= l4.w * x19; x48 -= l5.x * x20; x48 -= l5.y * x21; x48 -= l5.z * x22; x48 -= l5.w * x23; } __builtin_amdgcn_sched_barrier(0); { const v4f l6 = GDN_L4(48, 6); const v4f l7 = GDN_L4(48, 7); const v4f l8 = GDN_L4(48, 8); const v4f l9 = GDN_L4(48, 9); const v4f l10 = GDN_L4(48, 10); const v4f l11 = GDN_L4(48, 11); __builtin_amdgcn_sched_barrier(0); x48 -= l6.x * x24; x48 -= l6.y * x25; x48 -= l6.z * x26; x48 -= l6.w * x27; x48 -= l7.x * x28; x48 -= l7.y * x29; x48 -= l7.z * x30; x48 -= l7.w * x31; x48 -= l8.x * x32; x48 -= l8.y * x33; x48 -= l8.z * x34; x48 -= l8.w * x35; x48 -= l9.x * x36; x48 -= l9.y * x37; x48 -= l9.z * x38; x48 -= l9.w * x39; x48 -= l10.x * x40; x48 -= l10.y * x41; x48 -= l10.z * x42; x48 -= l10.w * x43; x48 -= l11.x * x44; x48 -= l11.y * x45; x48 -= l11.z * x46; x48 -= l11.w * x47; } __builtin_amdgcn_sched_barrier(0);
        float x49 = GDN_RHS(49); { const v4f l0 = GDN_L4(49, 0); const v4f l1 = GDN_L4(49, 1); const v4f l2 = GDN_L4(49, 2); const v4f l3 = GDN_L4(49, 3); const v4f l4 = GDN_L4(49, 4); const v4f l5 = GDN_L4(49, 5); __builtin_amdgcn_sched_barrier(0); x49 -= l0.x * x0; x49 -= l0.y * x1; x49 -= l0.z * x2; x49 -= l0.w * x3; x49 -= l1.x * x4; x49 -= l1.y * x5; x49 -= l1.z * x6; x49 -= l1.w * x7; x49 -= l2.x * x8; x49 -= l2.y * x9; x49 -= l2.z * x10; x49 -= l2.w * x11; x49 -= l3.x * x12; x49 -= l3.y * x13; x49 -= l3.z * x14; x49 -= l3.w * x15; x49 -= l4.x * x16; x49 -= l4.y * x17; x49 -= l4.z * x18; x49 -= l4.w * x19; x49 -= l5.x * x20; x49 -= l5.y * x21; x49 -= l5.z * x22; x49 -= l5.w * x23; } __builtin_amdgcn_sched_barrier(0); { const v4f l6 = GDN_L4(49, 6); const v4f l7 = GDN_L4(49, 7); const v4f l8 = GDN_L4(49, 8); const v4f l9 = GDN_L4(49, 9); const v4f l10 = GDN_L4(49, 10); const v4f l11 = GDN_L4(49, 11); __builtin_amdgcn_sched_barrier(0); x49 -= l6.x * x24; x49 -= l6.y * x25; x49 -= l6.z * x26; x49 -= l6.w * x27; x49 -= l7.x * x28; x49 -= l7.y * x29; x49 -= l7.z * x30; x49 -= l7.w * x31; x49 -= l8.x * x32; x49 -= l8.y * x33; x49 -= l8.z * x34; x49 -= l8.w * x35; x49 -= l9.x * x36; x49 -= l9.y * x37; x49 -= l9.z * x38; x49 -= l9.w * x39; x49 -= l10.x * x40; x49 -= l10.y * x41; x49 -= l10.z * x42; x49 -= l10.w * x43; x49 -= l11.x * x44; x49 -= l11.y * x45; x49 -= l11.z * x46; x49 -= l11.w * x47; } __builtin_amdgcn_sched_barrier(0); { const v4f l12 = GDN_L4(49, 12); __builtin_amdgcn_sched_barrier(0); x49 -= l12.x * x48; } __builtin_amdgcn_sched_barrier(0);
        float x50 = GDN_RHS(50); { const v4f l0 = GDN_L4(50, 0); const v4f l1 = GDN_L4(50, 1); const v4f l2 = GDN_L4(50, 2); const v4f l3 = GDN_L4(50, 3); const v4f l4 = GDN_L4(50, 4); const v4f l5 = GDN_L4(50, 5); __builtin_amdgcn_sched_barrier(0); x50 -= l0.x * x0; x50 -= l0.y * x1; x50 -= l0.z * x2; x50 -= l0.w * x3; x50 -= l1.x * x4; x50 -= l1.y * x5; x50 -= l1.z * x6; x50 -= l1.w * x7; x50 -= l2.x * x8; x50 -= l2.y * x9; x50 -= l2.z * x10; x50 -= l2.w * x11; x50 -= l3.x * x12; x50 -= l3.y * x13; x50 -= l3.z * x14; x50 -= l3.w * x15; x50 -= l4.x * x16; x50 -= l4.y * x17; x50 -= l4.z * x18; x50 -= l4.w * x19; x50 -= l5.x * x20; x50 -= l5.y * x21; x50 -= l5.z * x22; x50 -= l5.w * x23; } __builtin_amdgcn_sched_barrier(0); { const v4f l6 = GDN_L4(50, 6); const v4f l7 = GDN_L4(50, 7); const v4f l8 = GDN_L4(50, 8); const v4f l9 = GDN_L4(50, 9); const v4f l10 = GDN_L4(50, 10); const v4f l11 = GDN_L4(50, 11); __builtin_amdgcn_sched_barrier(0); x50 -= l6.x * x24; x50 -= l6.y * x25; x50 -= l6.z * x26; x50 -= l6.w * x27; x50 -= l7.x * x28; x50 -= l7.y * x29; x50 -= l7.z * x30; x50 -= l7.w * x31; x50 -= l8.x * x32; x50 -= l8.y * x33; x50 -= l8.z * x34; x50 -= l8.w * x35; x50 -= l9.x * x36; x50 -= l9.y * x37; x50 -= l9.z * x38; x50 -= l9.w * x39; x50 -= l10.x * x40; x50 -= l10.y * x41; x50 -= l10.z * x42; x50 -= l10.w * x43; x50 -= l11.x * x44; x50 -= l11.y * x45; x50 -= l11.z * x46; x50 -= l11.w * x47; } __builtin_amdgcn_sched_barrier(0); { const v4f l12 = GDN_L4(50, 12); __builtin_amdgcn_sched_barrier(0); x50 -= l12.x * x48; x50 -= l12.y * x49; } __builtin_amdgcn_sched_barrier(0);
        float x51 = GDN_RHS(51); { const v4f l0 = GDN_L4(51, 0); const v4f l1 = GDN_L4(51, 1); const v4f l2 = GDN_L4(51, 2); const v4f l3 = GDN_L4(51, 3); const v4f l4 = GDN_L4(51, 4); const v4f l5 = GDN_L4(51, 5); __builtin_amdgcn_sched_barrier(0); x51 -= l0.x * x0; x51 -= l0.y * x1; x51 -= l0.z * x2; x51 -= l0.w * x3; x51 -= l1.x * x4; x51 -= l1.y * x5; x51 -= l1.z * x6; x51 -= l1.w * x7; x51 -= l2.x * x8; x51 -= l2.y * x9; x51 -= l2.z * x10; x51 -= l2.w * x11; x51 -= l3.x * x12; x51 -= l3.y * x13; x51 -= l3.z * x14; x51 -= l3.w * x15; x51 -= l4.x * x16; x51 -= l4.y * x17; x51 -= l4.z * x18; x51 -= l4.w * x19; x51 -= l5.x * x20; x51 -= l5.y * x21; x51 -= l5.z * x22; x51 -= l5.w * x23; } __builtin_amdgcn_sched_barrier(0); { const v4f l6 = GDN_L4(51, 6); const v4f l7 = GDN_L4(51, 7); const v4f l8 = GDN_L4(51, 8); const v4f l9 = GDN_L4(51, 9); const v4f l10 = GDN_L4(51, 10); const v4f l11 = GDN_L4(51, 11); __builtin_amdgcn_sched_barrier(0); x51 -= l6.x * x24; x51 -= l6.y * x25; x51 -= l6.z * x26; x51 -= l6.w * x27; x51 -= l7.x * x28; x51 -= l7.y * x29; x51 -= l7.z * x30; x51 -= l7.w * x31; x51 -= l8.x * x32; x51 -= l8.y * x33; x51 -= l8.z * x34; x51 -= l8.w * x35; x51 -= l9.x * x36; x51 -= l9.y * x37; x51 -= l9.z * x38; x51 -= l9.w * x39; x51 -= l10.x * x40; x51 -= l10.y * x41; x51 -= l10.z * x42; x51 -= l10.w * x43; x51 -= l11.x * x44; x51 -= l11.y * x45; x51 -= l11.z * x46; x51 -= l11.w * x47; } __builtin_amdgcn_sched_barrier(0); { const v4f l12 = GDN_L4(51, 12); __builtin_amdgcn_sched_barrier(0); x51 -= l12.x * x48; x51 -= l12.y * x49; x51 -= l12.z * x50; } __builtin_amdgcn_sched_barrier(0);
        float x52 = GDN_RHS(52); { const v4f l0 = GDN_L4(52, 0); const v4f l1 = GDN_L4(52, 1); const v4f l2 = GDN_L4(52, 2); const v4f l3 = GDN_L4(52, 3); const v4f l4 = GDN_L4(52, 4); const v4f l5 = GDN_L4(52, 5); __builtin_amdgcn_sched_barrier(0); x52 -= l0.x * x0; x52 -= l0.y * x1; x52 -= l0.z * x2; x52 -= l0.w * x3; x52 -= l1.x * x4; x52 -= l1.y * x5; x52 -= l1.z * x6; x52 -= l1.w * x7; x52 -= l2.x * x8; x52 -= l2.y * x9; x52 -= l2.z * x10; x52 -= l2.w * x11; x52 -= l3.x * x12; x52 -= l3.y * x13; x52 -= l3.z * x14; x52 -= l3.w * x15; x52 -= l4.x * x16; x52 -= l4.y * x17; x52 -= l4.z * x18; x52 -= l4.w * x19; x52 -= l5.x * x20; x52 -= l5.y * x21; x52 -= l5.z * x22; x52 -= l5.w * x23; } __builtin_amdgcn_sched_barrier(0); { const v4f l6 = GDN_L4(52, 6); const v4f l7 = GDN_L4(52, 7); const v4f l8 = GDN_L4(52, 8); const v4f l9 = GDN_L4(52, 9); const v4f l10 = GDN_L4(52, 10); const v4f l11 = GDN_L4(52, 11); __builtin_amdgcn_sched_barrier(0); x52 -= l6.x * x24; x52 -= l6.y * x25; x52 -= l6.z * x26; x52 -= l6.w * x27; x52 -= l7.x * x28; x52 -= l7.y * x29; x52 -= l7.z * x30; x52 -= l7.w * x31; x52 -= l8.x * x32; x52 -= l8.y * x33; x52 -= l8.z * x34; x52 -= l8.w * x35; x52 -= l9.x * x36; x52 -= l9.y * x37; x52 -= l9.z * x38; x52 -= l9.w * x39; x52 -= l10.x * x40; x52 -= l10.y * x41; x52 -= l10.z * x42; x52 -= l10.w * x43; x52 -= l11.x * x44; x52 -= l11.y * x45; x52 -= l11.z * x46; x52 -= l11.w * x47; } __builtin_amdgcn_sched_barrier(0); { const v4f l12 = GDN_L4(52, 12); __builtin_amdgcn_sched_barrier(0); x52 -= l12.x * x48; x52 -= l12.y * x49; x52 -= l12.z * x50; x52 -= l12.w * x51; } __builtin_amdgcn_sched_barrier(0);
        float x53 = GDN_RHS(53); { const v4f l0 = GDN_L4(53, 0); const v4f l1 = GDN_L4(53, 1); const v4f l2 = GDN_L4(53, 2); const v4f l3 = GDN_L4(53, 3); const v4f l4 = GDN_L4(53, 4); const v4f l5 = GDN_L4(53, 5); __builtin_amdgcn_sched_barrier(0); x53 -= l0.x * x0; x53 -= l0.y * x1; x53 -= l0.z * x2; x53 -= l0.w * x3; x53 -= l1.x * x4; x53 -= l1.y * x5; x53 -= l1.z * x6; x53 -= l1.w * x7; x53 -= l2.x * x8; x53 -= l2.y * x9; x53 -= l2.z * x10; x53 -= l2.w * x11; x53 -= l3.x * x12; x53 -= l3.y * x13; x53 -= l3.z * x14; x53 -= l3.w * x15; x53 -= l4.x * x16; x53 -= l4.y * x17; x53 -= l4.z * x18; x53 -= l4.w * x19; x53 -= l5.x * x20; x53 -= l5.y * x21; x53 -= l5.z * x22; x53 -= l5.w * x23; } __builtin_amdgcn_sched_barrier(0); { const v4f l6 = GDN_L4(53, 6); const v4f l7 = GDN_L4(53, 7); const v4f l8 = GDN_L4(53, 8); const v4f l9 = GDN_L4(53, 9); const v4f l10 = GDN_L4(53, 10); const v4f l11 = GDN_L4(53, 11); __builtin_amdgcn_sched_barrier(0); x53 -= l6.x * x24; x53 -= l6.y * x25; x53 -= l6.z * x26; x53 -= l6.w * x27; x53 -= l7.x * x28; x53 -= l7.y * x29; x53 -= l7.z * x30; x53 -= l7.w * x31; x53 -= l8.x * x32; x53 -= l8.y * x33; x53 -= l8.z * x34; x53 -= l8.w * x35; x53 -= l9.x * x36; x53 -= l9.y * x37; x53 -= l9.z * x38; x53 -= l9.w * x39; x53 -= l10.x * x40; x53 -= l10.y * x41; x53 -= l10.z * x42; x53 -= l10.w * x43; x53 -= l11.x * x44; x53 -= l11.y * x45; x53 -= l11.z * x46; x53 -= l11.w * x47; } __builtin_amdgcn_sched_barrier(0); { const v4f l12 = GDN_L4(53, 12); const v4f l13 = GDN_L4(53, 13); __builtin_amdgcn_sched_barrier(0); x53 -= l12.x * x48; x53 -= l12.y * x49; x53 -= l12.z * x50; x53 -= l12.w * x51; x53 -= l13.x * x52; } __builtin_amdgcn_sched_barrier(0);
        float x54 = GDN_RHS(54); { const v4f l0 = GDN_L4(54, 0); const v4f l1 = GDN_L4(54, 1); const v4f l2 = GDN_L4(54, 2); const v4f l3 = GDN_L4(54, 3); const v4f l4 = GDN_L4(54, 4); const v4f l5 = GDN_L4(54, 5); __builtin_amdgcn_sched_barrier(0); x54 -= l0.x * x0; x54 -= l0.y * x1; x54 -= l0.z * x2; x54 -= l0.w * x3; x54 -= l1.x * x4; x54 -= l1.y * x5; x54 -= l1.z * x6; x54 -= l1.w * x7; x54 -= l2.x * x8; x54 -= l2.y * x9; x54 -= l2.z * x10; x54 -= l2.w * x11; x54 -= l3.x * x12; x54 -= l3.y * x13; x54 -= l3.z * x14; x54 -= l3.w * x15; x54 -= l4.x * x16; x54 -= l4.y * x17; x54 -= l4.z * x18; x54 -= l4.w * x19; x54 -= l5.x * x20; x54 -= l5.y * x21; x54 -= l5.z * x22; x54 -= l5.w * x23; } __builtin_amdgcn_sched_barrier(0); { const v4f l6 = GDN_L4(54, 6); const v4f l7 = GDN_L4(54, 7); const v4f l8 = GDN_L4(54, 8); const v4f l9 = GDN_L4(54, 9); const v4f l10 = GDN_L4(54, 10); const v4f l11 = GDN_L4(54, 11); __builtin_amdgcn_sched_barrier(0); x54 -= l6.x * x24; x54 -= l6.y * x25; x54 -= l6.z * x26; x54 -= l6.w * x27; x54 -= l7.x * x28; x54 -= l7.y * x29; x54 -= l7.z * x30; x54 -= l7.w * x31; x54 -= l8.x * x32; x54 -= l8.y * x33; x54 -= l8.z * x34; x54 -= l8.w * x35; x54 -= l9.x * x36; x54 -= l9.y * x37; x54 -= l9.z * x38; x54 -= l9.w * x39; x54 -= l10.x * x40; x54 -= l10.y * x41; x54 -= l10.z * x42; x54 -= l10.w * x43; x54 -= l11.x * x44; x54 -= l11.y * x45; x54 -= l11.z * x46; x54 -= l11.w * x47; } __builtin_amdgcn_sched_barrier(0); { const v4f l12 = GDN_L4(54, 12); const v4f l13 = GDN_L4(54, 13); __builtin_amdgcn_sched_barrier(0); x54 -= l12.x * x48; x54 -= l12.y * x49; x54 -= l12.z * x50; x54 -= l12.w * x51; x54 -= l13.x * x52; x54 -= l13.y * x53; } __builtin_amdgcn_sched_barrier(0);
        float x55 = GDN_RHS(55); { const v4f l0 = GDN_L4(55, 0); const v4f l1 = GDN_L4(55, 1); const v4f l2 = GDN_L4(55, 2); const v4f l3 = GDN_L4(55, 3); const v4f l4 = GDN_L4(55, 4); const v4f l5 = GDN_L4(55, 5); __builtin_amdgcn_sched_barrier(0); x55 -= l0.x * x0; x55 -= l0.y * x1; x55 -= l0.z * x2; x55 -= l0.w * x3; x55 -= l1.x * x4; x55 -= l1.y * x5; x55 -= l1.z * x6; x55 -= l1.w * x7; x55 -= l2.x * x8; x55 -= l2.y * x9; x55 -= l2.z * x10; x55 -= l2.w * x11; x55 -= l3.x * x12; x55 -= l3.y * x13; x55 -= l3.z * x14; x55 -= l3.w * x15; x55 -= l4.x * x16; x55 -= l4.y * x17; x55 -= l4.z * x18; x55 -= l4.w * x19; x55 -= l5.x * x20; x55 -= l5.y * x21; x55 -= l5.z * x22; x55 -= l5.w * x23; } __builtin_amdgcn_sched_barrier(0); { const v4f l6 = GDN_L4(55, 6); const v4f l7 = GDN_L4(55, 7); const v4f l8 = GDN_L4(55, 8); const v4f l9 = GDN_L4(55, 9); const v4f l10 = GDN_L4(55, 10); const v4f l11 = GDN_L4(55, 11); __builtin_amdgcn_sched_barrier(0); x55 -= l6.x * x24; x55 -= l6.y * x25; x55 -= l6.z * x26; x55 -= l6.w * x27; x55 -= l7.x * x28; x55 -= l7.y * x29; x55 -= l7.z * x30; x55 -= l7.w * x31; x55 -= l8.x * x32; x55 -= l8.y * x33; x55 -= l8.z * x34; x55 -= l8.w * x35; x55 -= l9.x * x36; x55 -= l9.y * x37; x55 -= l9.z * x38; x55 -= l9.w * x39; x55 -= l10.x * x40; x55 -= l10.y * x41; x55 -= l10.z * x42; x55 -= l10.w * x43; x55 -= l11.x * x44; x55 -= l11.y * x45; x55 -= l11.z * x46; x55 -= l11.w * x47; } __builtin_amdgcn_sched_barrier(0); { const v4f l12 = GDN_L4(55, 12); const v4f l13 = GDN_L4(55, 13); __builtin_amdgcn_sched_barrier(0); x55 -= l12.x * x48; x55 -= l12.y * x49; x55 -= l12.z * x50; x55 -= l12.w * x51; x55 -= l13.x * x52; x55 -= l13.y * x53; x55 -= l13.z * x54; } __builtin_amdgcn_sched_barrier(0);
        float x56 = GDN_RHS(56); { const v4f l0 = GDN_L4(56, 0); const v4f l1 = GDN_L4(56, 1); const v4f l2 = GDN_L4(56, 2); const v4f l3 = GDN_L4(56, 3); const v4f l4 = GDN_L4(56, 4); const v4f l5 = GDN_L4(56, 5); __builtin_amdgcn_sched_barrier(0); x56 -= l0.x * x0; x56 -= l0.y * x1; x56 -= l0.z * x2; x56 -= l0.w * x3; x56 -= l1.x * x4; x56 -= l1.y * x5; x56 -= l1.z * x6; x56 -= l1.w * x7; x56 -= l2.x * x8; x56 -= l2.y * x9; x56 -= l2.z * x10; x56 -= l2.w * x11; x56 -= l3.x * x12; x56 -= l3.y * x13; x56 -= l3.z * x14; x56 -= l3.w * x15; x56 -= l4.x * x16; x56 -= l4.y * x17; x56 -= l4.z * x18; x56 -= l4.w * x19; x56 -= l5.x * x20; x56 -= l5.y * x21; x56 -= l5.z * x22; x56 -= l5.w * x23; } __builtin_amdgcn_sched_barrier(0); { const v4f l6 = GDN_L4(56, 6); const v4f l7 = GDN_L4(56, 7); const v4f l8 = GDN_L4(56, 8); const v4f l9 = GDN_L4(56, 9); const v4f l10 = GDN_L4(56, 10); const v4f l11 = GDN_L4(56, 11); __builtin_amdgcn_sched_barrier(0); x56 -= l6.x * x24; x56 -= l6.y * x25; x56 -= l6.z * x26; x56 -= l6.w * x27; x56 -= l7.x * x28; x56 -= l7.y * x29; x56 -= l7.z * x30; x56 -= l7.w * x31; x56 -= l8.x * x32; x56 -= l8.y * x33; x56 -= l8.z * x34; x56 -= l8.w * x35; x56 -= l9.x * x36; x56 -= l9.y * x37; x56 -= l9.z * x38; x56 -= l9.w * x39; x56 -= l10.x * x40; x56 -= l10.y * x41; x56 -= l10.z * x42; x56 -= l10.w * x43; x56 -= l11.x * x44; x56 -= l11.y * x45; x56 -= l11.z * x46; x56 -= l11.w * x47; } __builtin_amdgcn_sched_barrier(0); { const v4f l12 = GDN_L4(56, 12); const v4f l13 = GDN_L4(56, 13); __builtin_amdgcn_sched_barrier(0); x56 -= l12.x * x48; x56 -= l12.y * x49; x56 -= l12.z * x50; x56 -= l12.w * x51; x56 -= l13.x * x52; x56 -= l13.y * x53; x56 -= l13.z * x54; x56 -= l13.w * x55; } __builtin_amdgcn_sched_barrier(0);
        float x57 = GDN_RHS(57); { const v4f l0 = GDN_L4(57, 0); const v4f l1 = GDN_L4(57, 1); const v4f l2 = GDN_L4(57, 2); const v4f l3 = GDN_L4(57, 3); const v4f l4 = GDN_L4(57, 4); const v4f l5 = GDN_L4(57, 5); __builtin_amdgcn_sched_barrier(0); x57 -= l0.x * x0; x57 -= l0.y * x1; x57 -= l0.z * x2; x57 -= l0.w * x3; x57 -= l1.x * x4; x57 -= l1.y * x5; x57 -= l1.z * x6; x57 -= l1.w * x7; x57 -= l2.x * x8; x57 -= l2.y * x9; x57 -= l2.z * x10; x57 -= l2.w * x11; x57 -= l3.x * x12; x57 -= l3.y * x13; x57 -= l3.z * x14; x57 -= l3.w * x15; x57 -= l4.x * x16; x57 -= l4.y * x17; x57 -= l4.z * x18; x57 -= l4.w * x19; x57 -= l5.x * x20; x57 -= l5.y * x21; x57 -= l5.z * x22; x57 -= l5.w * x23; } __builtin_amdgcn_sched_barrier(0); { const v4f l6 = GDN_L4(57, 6); const v4f l7 = GDN_L4(57, 7); const v4f l8 = GDN_L4(57, 8); const v4f l9 = GDN_L4(57, 9); const v4f l10 = GDN_L4(57, 10); const v4f l11 = GDN_L4(57, 11); __builtin_amdgcn_sched_barrier(0); x57 -= l6.x * x24; x57 -= l6.y * x25; x57 -= l6.z * x26; x57 -= l6.w * x27; x57 -= l7.x * x28; x57 -= l7.y * x29; x57 -= l7.z * x30; x57 -= l7.w * x31; x57 -= l8.x * x32; x57 -= l8.y * x33; x57 -= l8.z * x34; x57 -= l8.w * x35; x57 -= l9.x * x36; x57 -= l9.y * x37; x57 -= l9.z * x38; x57 -= l9.w * x39; x57 -= l10.x * x40; x57 -= l10.y * x41; x57 -= l10.z * x42; x57 -= l10.w * x43; x57 -= l11.x * x44; x57 -= l11.y * x45; x57 -= l11.z * x46; x57 -= l11.w * x47; } __builtin_amdgcn_sched_barrier(0); { const v4f l12 = GDN_L4(57, 12); const v4f l13 = GDN_L4(57, 13); const v4f l14 = GDN_L4(57, 14); __builtin_amdgcn_sched_barrier(0); x57 -= l12.x * x48; x57 -= l12.y * x49; x57 -= l12.z * x50; x57 -= l12.w * x51; x57 -= l13.x * x52; x57 -= l13.y * x53; x57 -= l13.z * x54; x57 -= l13.w * x55; x57 -= l14.x * x56; } __builtin_amdgcn_sched_barrier(0);
        float x58 = GDN_RHS(58); { const v4f l0 = GDN_L4(58, 0); const v4f l1 = GDN_L4(58, 1); const v4f l2 = GDN_L4(58, 2); const v4f l3 = GDN_L4(58, 3); const v4f l4 = GDN_L4(58, 4); const v4f l5 = GDN_L4(58, 5); __builtin_amdgcn_sched_barrier(0); x58 -= l0.x * x0; x58 -= l0.y * x1; x58 -= l0.z * x2; x58 -= l0.w * x3; x58 -= l1.x * x4; x58 -= l1.y * x5; x58 -= l1.z * x6; x58 -= l1.w * x7; x58 -= l2.x * x8; x58 -= l2.y * x9; x58 -= l2.z * x10; x58 -= l2.w * x11; x58 -= l3.x * x12; x58 -= l3.y * x13; x58 -= l3.z * x14; x58 -= l3.w * x15; x58 -= l4.x * x16; x58 -= l4.y * x17; x58 -= l4.z * x18; x58 -= l4.w * x19; x58 -= l5.x * x20; x58 -= l5.y * x21; x58 -= l5.z * x22; x58 -= l5.w * x23; } __builtin_amdgcn_sched_barrier(0); { const v4f l6 = GDN_L4(58, 6); const v4f l7 = GDN_L4(58, 7); const v4f l8 = GDN_L4(58, 8); const v4f l9 = GDN_L4(58, 9); const v4f l10 = GDN_L4(58, 10); const v4f l11 = GDN_L4(58, 11); __builtin_amdgcn_sched_barrier(0); x58 -= l6.x * x24; x58 -= l6.y * x25; x58 -= l6.z * x26; x58 -= l6.w * x27; x58 -= l7.x * x28; x58 -= l7.y * x29; x58 -= l7.z * x30; x58 -= l7.w * x31; x58 -= l8.x * x32; x58 -= l8.y * x33; x58 -= l8.z * x34; x58 -= l8.w * x35; x58 -= l9.x * x36; x58 -= l9.y * x37; x58 -= l9.z * x38; x58 -= l9.w * x39; x58 -= l10.x * x40; x58 -= l10.y * x41; x58 -= l10.z * x42; x58 -= l10.w * x43; x58 -= l11.x * x44; x58 -= l11.y * x45; x58 -= l11.z * x46; x58 -= l11.w * x47; } __builtin_amdgcn_sched_barrier(0); { const v4f l12 = GDN_L4(58, 12); const v4f l13 = GDN_L4(58, 13); const v4f l14 = GDN_L4(58, 14); __builtin_amdgcn_sched_barrier(0); x58 -= l12.x * x48; x58 -= l12.y * x49; x58 -= l12.z * x50; x58 -= l12.w * x51; x58 -= l13.x * x52; x58 -= l13.y * x53; x58 -= l13.z * x54; x58 -= l13.w * x55; x58 -= l14.x * x56; x58 -= l14.y * x57; } __builtin_amdgcn_sched_barrier(0);
        float x59 = GDN_RHS(59); { const v4f l0 = GDN_L4(59, 0); const v4f l1 = GDN_L4(59, 1); const v4f l2 = GDN_L4(59, 2); const v4f l3 = GDN_L4(59, 3); const v4f l4 = GDN_L4(59, 4); const v4f l5 = GDN_L4(59, 5); __builtin_amdgcn_sched_barrier(0); x59 -= l0.x * x0; x59 -= l0.y * x1; x59 -= l0.z * x2; x59 -= l0.w * x3; x59 -= l1.x * x4; x59 -= l1.y * x5; x59 -= l1.z * x6; x59 -= l1.w * x7; x59 -= l2.x * x8; x59 -= l2.y * x9; x59 -= l2.z * x10; x59 -= l2.w * x11; x59 -= l3.x * x12; x59 -= l3.y * x13; x59 -= l3.z * x14; x59 -= l3.w * x15; x59 -= l4.x * x16; x59 -= l4.y * x17; x59 -= l4.z * x18; x59 -= l4.w * x19; x59 -= l5.x * x20; x59 -= l5.y * x21; x59 -= l5.z * x22; x59 -= l5.w * x23; } __builtin_amdgcn_sched_barrier(0); { const v4f l6 = GDN_L4(59, 6); const v4f l7 = GDN_L4(59, 7); const v4f l8 = GDN_L4(59, 8); const v4f l9 = GDN_L4(59, 9); const v4f l10 = GDN_L4(59, 10); const v4f l11 = GDN_L4(59, 11); __builtin_amdgcn_sched_barrier(0); x59 -= l6.x * x24; x59 -= l6.y * x25; x59 -= l6.z * x26; x59 -= l6.w * x27; x59 -= l7.x * x28; x59 -= l7.y * x29; x59 -= l7.z * x30; x59 -= l7.w * x31; x59 -= l8.x * x32; x59 -= l8.y * x33; x59 -= l8.z * x34; x59 -= l8.w * x35; x59 -= l9.x * x36; x59 -= l9.y * x37; x59 -= l9.z * x38; x59 -= l9.w * x39; x59 -= l10.x * x40; x59 -= l10.y * x41; x59 -= l10.z * x42; x59 -= l10.w * x43; x59 -= l11.x * x44; x59 -= l11.y * x45; x59 -= l11.z * x46; x59 -= l11.w * x47; } __builtin_amdgcn_sched_barrier(0); { const v4f l12 = GDN_L4(59, 12); const v4f l13 = GDN_L4(59, 13); const v4f l14 = GDN_L4(59, 14); __builtin_amdgcn_sched_barrier(0); x59 -= l12.x * x48; x59 -= l12.y * x49; x59 -= l12.z * x50; x59 -= l12.w * x51; x59 -= l13.x * x52; x59 -= l13.y * x53; x59 -= l13.z * x54; x59 -= l13.w * x55; x59 -= l14.x * x56; x59 -= l14.y * x57; x59 -= l14.z * x58; } __builtin_amdgcn_sched_barrier(0);
        float x60 = GDN_RHS(60); { const v4f l0 = GDN_L4(60, 0); const v4f l1 = GDN_L4(60, 1); const v4f l2 = GDN_L4(60, 2); const v4f l3 = GDN_L4(60, 3); const v4f l4 = GDN_L4(60, 4); const v4f l5 = GDN_L4(60, 5); __builtin_amdgcn_sched_barrier(0); x60 -= l0.x * x0; x60 -= l0.y * x1; x60 -= l0.z * x2; x60 -= l0.w * x3; x60 -= l1.x * x4; x60 -= l1.y * x5; x60 -= l1.z * x6; x60 -= l1.w * x7; x60 -= l2.x * x8; x60 -= l2.y * x9; x60 -= l2.z * x10; x60 -= l2.w * x11; x60 -= l3.x * x12; x60 -= l3.y * x13; x60 -= l3.z * x14; x60 -= l3.w * x15; x60 -= l4.x * x16; x60 -= l4.y * x17; x60 -= l4.z * x18; x60 -= l4.w * x19; x60 -= l5.x * x20; x60 -= l5.y * x21; x60 -= l5.z * x22; x60 -= l5.w * x23; } __builtin_amdgcn_sched_barrier(0); { const v4f l6 = GDN_L4(60, 6); const v4f l7 = GDN_L4(60, 7); const v4f l8 = GDN_L4(60, 8); const v4f l9 = GDN_L4(60, 9); const v4f l10 = GDN_L4(60, 10); const v4f l11 = GDN_L4(60, 11); __builtin_amdgcn_sched_barrier(0); x60 -= l6.x * x24; x60 -= l6.y * x25; x60 -= l6.z * x26; x60 -= l6.w * x27; x60 -= l7.x * x28; x60 -= l7.y * x29; x60 -= l7.z * x30; x60 -= l7.w * x31; x60 -= l8.x * x32; x60 -= l8.y * x33; x60 -= l8.z * x34; x60 -= l8.w * x35; x60 -= l9.x * x36; x60 -= l9.y * x37; x60 -= l9.z * x38; x60 -= l9.w * x39; x60 -= l10.x * x40; x60 -= l10.y * x41; x60 -= l10.z * x42; x60 -= l10.w * x43; x60 -= l11.x * x44; x60 -= l11.y * x45; x60 -= l11.z * x46; x60 -= l11.w * x47; } __builtin_amdgcn_sched_barrier(0); { const v4f l12 = GDN_L4(60, 12); const v4f l13 = GDN_L4(60, 13); const v4f l14 = GDN_L4(60, 14); __builtin_amdgcn_sched_barrier(0); x60 -= l12.x * x48; x60 -= l12.y * x49; x60 -= l12.z * x50; x60 -= l12.w * x51; x60 -= l13.x * x52; x60 -= l13.y * x53; x60 -= l13.z * x54; x60 -= l13.w * x55; x60 -= l14.x * x56; x60 -= l14.y * x57; x60 -= l14.z * x58; x60 -= l14.w * x59; } __builtin_amdgcn_sched_barrier(0);
        float x61 = GDN_RHS(61); { const v4f l0 = GDN_L4(61, 0); const v4f l1 = GDN_L4(61, 1); const v4f l2 = GDN_L4(61, 2); const v4f l3 = GDN_L4(61, 3); const v4f l4 = GDN_L4(61, 4); const v4f l5 = GDN_L4(61, 5); __builtin_amdgcn_sched_barrier(0); x61 -= l0.x * x0; x61 -= l0.y * x1; x61 -= l0.z * x2; x61 -= l0.w * x3; x61 -= l1.x * x4; x61 -= l1.y * x5; x61 -= l1.z * x6; x61 -= l1.w * x7; x61 -= l2.x * x8; x61 -= l2.y * x9; x61 -= l2.z * x10; x61 -= l2.w * x11; x61 -= l3.x * x12; x61 -= l3.y * x13; x61 -= l3.z * x14; x61 -= l3.w * x15; x61 -= l4.x * x16; x61 -= l4.y * x17; x61 -= l4.z * x18; x61 -= l4.w * x19; x61 -= l5.x * x20; x61 -= l5.y * x21; x61 -= l5.z * x22; x61 -= l5.w * x23; } __builtin_amdgcn_sched_barrier(0); { const v4f l6 = GDN_L4(61, 6); const v4f l7 = GDN_L4(61, 7); const v4f l8 = GDN_L4(61, 8); const v4f l9 = GDN_L4(61, 9); const v4f l10 = GDN_L4(61, 10); const v4f l11 = GDN_L4(61, 11); __builtin_amdgcn_sched_barrier(0); x61 -= l6.x * x24; x61 -= l6.y * x25; x61 -= l6.z * x26; x61 -= l6.w * x27; x61 -= l7.x * x28; x61 -= l7.y * x29; x61 -= l7.z * x30; x61 -= l7.w * x31; x61 -= l8.x * x32; x61 -= l8.y * x33; x61 -= l8.z * x34; x61 -= l8.w * x35; x61 -= l9.x * x36; x61 -= l9.y * x37; x61 -= l9.z * x38; x61 -= l9.w * x39; x61 -= l10.x * x40; x61 -= l10.y * x41; x61 -= l10.z * x42; x61 -= l10.w * x43; x61 -= l11.x * x44; x61 -= l11.y * x45; x61 -= l11.z * x46; x61 -= l11.w * x47; } __builtin_amdgcn_sched_barrier(0); { const v4f l12 = GDN_L4(61, 12); const v4f l13 = GDN_L4(61, 13); const v4f l14 = GDN_L4(61, 14); const v4f l15 = GDN_L4(61, 15); __builtin_amdgcn_sched_barrier(0); x61 -= l12.x * x48; x61 -= l12.y * x49; x61 -= l12.z * x50; x61 -= l12.w * x51; x61 -= l13.x * x52; x61 -= l13.y * x53; x61 -= l13.z * x54; x61 -= l13.w * x55; x61 -= l14.x * x56; x61 -= l14.y * x57; x61 -= l14.z * x58; x61 -= l14.w * x59; x61 -= l15.x * x60; } __builtin_amdgcn_sched_barrier(0);
        float x62 = GDN_RHS(62); { const v4f l0 = GDN_L4(62, 0); const v4f l1 = GDN_L4(62, 1); const v4f l2 = GDN_L4(62, 2); const v4f l3 = GDN_L4(62, 3); const v4f l4 = GDN_L4(62, 4); const v4f l5 = GDN_L4(62, 5); __builtin_amdgcn_sched_barrier(0); x62 -= l0.x * x0; x62 -= l0.y * x1; x62 -= l0.z * x2; x62 -= l0.w * x3; x62 -= l1.x * x4; x62 -= l1.y * x5; x62 -= l1.z * x6; x62 -= l1.w * x7; x62 -= l2.x * x8; x62 -= l2.y * x9; x62 -= l2.z * x10; x62 -= l2.w * x11; x62 -= l3.x * x12; x62 -= l3.y * x13; x62 -= l3.z * x14; x62 -= l3.w * x15; x62 -= l4.x * x16; x62 -= l4.y * x17; x62 -= l4.z * x18; x62 -= l4.w * x19; x62 -= l5.x * x20; x62 -= l5.y * x21; x62 -= l5.z * x22; x62 -= l5.w * x23; } __builtin_amdgcn_sched_barrier(0); { const v4f l6 = GDN_L4(62, 6); const v4f l7 = GDN_L4(62, 7); const v4f l8 = GDN_L4(62, 8); const v4f l9 = GDN_L4(62, 9); const v4f l10 = GDN_L4(62, 10); const v4f l11 = GDN_L4(62, 11); __builtin_amdgcn_sched_barrier(0); x62 -= l6.x * x24; x62 -= l6.y * x25; x62 -= l6.z * x26; x62 -= l6.w * x27; x62 -= l7.x * x28; x62 -= l7.y * x29; x62 -= l7.z * x30; x62 -= l7.w * x31; x62 -= l8.x * x32; x62 -= l8.y * x33; x62 -= l8.z * x34; x62 -= l8.w * x35; x62 -= l9.x * x36; x62 -= l9.y * x37; x62 -= l9.z * x38; x62 -= l9.w * x39; x62 -= l10.x * x40; x62 -= l10.y * x41; x62 -= l10.z * x42; x62 -= l10.w * x43; x62 -= l11.x * x44; x62 -= l11.y * x45; x62 -= l11.z * x46; x62 -= l11.w * x47; } __builtin_amdgcn_sched_barrier(0); { const v4f l12 = GDN_L4(62, 12); const v4f l13 = GDN_L4(62, 13); const v4f l14 = GDN_L4(62, 14); const v4f l15 = GDN_L4(62, 15); __builtin_amdgcn_sched_barrier(0); x62 -= l12.x * x48; x62 -= l12.y * x49; x62 -= l12.z * x50; x62 -= l12.w * x51; x62 -= l13.x * x52; x62 -= l13.y * x53; x62 -= l13.z * x54; x62 -= l13.w * x55; x62 -= l14.x * x56; x62 -= l14.y * x57; x62 -= l14.z * x58; x62 -= l14.w * x59; x62 -= l15.x * x60; x62 -= l15.y * x61; } __builtin_amdgcn_sched_barrier(0);
        float x63 = GDN_RHS(63); { const v4f l0 = GDN_L4(63, 0); const v4f l1 = GDN_L4(63, 1); const v4f l2 = GDN_L4(63, 2); const v4f l3 = GDN_L4(63, 3); const v4f l4 = GDN_L4(63, 4); const v4f l5 = GDN_L4(63, 5); __builtin_amdgcn_sched_barrier(0); x63 -= l0.x * x0; x63 -= l0.y * x1; x63 -= l0.z * x2; x63 -= l0.w * x3; x63 -= l1.x * x4; x63 -= l1.y * x5; x63 -= l1.z * x6; x63 -= l1.w * x7; x63 -= l2.x * x8; x63 -= l2.y * x9; x63 -= l2.z * x10; x63 -= l2.w * x11; x63 -= l3.x * x12; x63 -= l3.y * x13; x63 -= l3.z * x14; x63 -= l3.w * x15; x63 -= l4.x * x16; x63 -= l4.y * x17; x63 -= l4.z * x18; x63 -= l4.w * x19; x63 -= l5.x * x20; x63 -= l5.y * x21; x63 -= l5.z * x22; x63 -= l5.w * x23; } __builtin_amdgcn_sched_barrier(0); { const v4f l6 = GDN_L4(63, 6); const v4f l7 = GDN_L4(63, 7); const v4f l8 = GDN_L4(63, 8); const v4f l9 = GDN_L4(63, 9); const v4f l10 = GDN_L4(63, 10); const v4f l11 = GDN_L4(63, 11); __builtin_amdgcn_sched_barrier(0); x63 -= l6.x * x24; x63 -= l6.y * x25; x63 -= l6.z * x26; x63 -= l6.w * x27; x63 -= l7.x * x28; x63 -= l7.y * x29; x63 -= l7.z * x30; x63 -= l7.w * x31; x63 -= l8.x * x32; x63 -= l8.y * x33; x63 -= l8.z * x34; x63 -= l8.w * x35; x63 -= l9.x * x36; x63 -= l9.y * x37; x63 -= l9.z * x38; x63 -= l9.w * x39; x63 -= l10.x * x40; x63 -= l10.y * x41; x63 -= l10.z * x42; x63 -= l10.w * x43; x63 -= l11.x * x44; x63 -= l11.y * x45; x63 -= l11.z * x46; x63 -= l11.w * x47; } __builtin_amdgcn_sched_barrier(0); { const v4f l12 = GDN_L4(63, 12); const v4f l13 = GDN_L4(63, 13); const v4f l14 = GDN_L4(63, 14); const v4f l15 = GDN_L4(63, 15); __builtin_amdgcn_sched_barrier(0); x63 -= l12.x * x48; x63 -= l12.y * x49; x63 -= l12.z * x50; x63 -= l12.w * x51; x63 -= l13.x * x52; x63 -= l13.y * x53; x63 -= l13.z * x54; x63 -= l13.w * x55; x63 -= l14.x * x56; x63 -= l14.y * x57; x63 -= l14.z * x58; x63 -= l14.w * x59; x63 -= l15.x * x60; x63 -= l15.y * x61; x63 -= l15.z * x62; } __builtin_amdgcn_sched_barrier(0);
        if (c < 128) { GU[0 * 128 + c] = x0; GU[1 * 128 + c] = x1; GU[2 * 128 + c] = x2; GU[3 * 128 + c] = x3; GU[4 * 128 + c] = x4; GU[5 * 128 + c] = x5; GU[6 * 128 + c] = x6; GU[7 * 128 + c] = x7; GU[8 * 128 + c] = x8; GU[9 * 128 + c] = x9; GU[10 * 128 + c] = x10; GU[11 * 128 + c] = x11; GU[12 * 128 + c] = x12; GU[13 * 128 + c] = x13; GU[14 * 128 + c] = x14; GU[15 * 128 + c] = x15; GU[16 * 128 + c] = x16; GU[17 * 128 + c] = x17; GU[18 * 128 + c] = x18; GU[19 * 128 + c] = x19; GU[20 * 128 + c] = x20; GU[21 * 128 + c] = x21; GU[22 * 128 + c] = x22; GU[23 * 128 + c] = x23; GU[24 * 128 + c] = x24; GU[25 * 128 + c] = x25; GU[26 * 128 + c] = x26; GU[27 * 128 + c] = x27; GU[28 * 128 + c] = x28; GU[29 * 128 + c] = x29; GU[30 * 128 + c] = x30; GU[31 * 128 + c] = x31; GU[32 * 128 + c] = x32; GU[33 * 128 + c] = x33; GU[34 * 128 + c] = x34; GU[35 * 128 + c] = x35; GU[36 * 128 + c] = x36; GU[37 * 128 + c] = x37; GU[38 * 128 + c] = x38; GU[39 * 128 + c] = x39; GU[40 * 128 + c] = x40; GU[41 * 128 + c] = x41; GU[42 * 128 + c] = x42; GU[43 * 128 + c] = x43; GU[44 * 128 + c] = x44; GU[45 * 128 + c] = x45; GU[46 * 128 + c] = x46; GU[47 * 128 + c] = x47; GU[48 * 128 + c] = x48; GU[49 * 128 + c] = x49; GU[50 * 128 + c] = x50; GU[51 * 128 + c] = x51; GU[52 * 128 + c] = x52; GU[53 * 128 + c] = x53; GU[54 * 128 + c] = x54; GU[55 * 128 + c] = x55; GU[56 * 128 + c] = x56; GU[57 * 128 + c] = x57; GU[58 * 128 + c] = x58; GU[59 * 128 + c] = x59; GU[60 * 128 + c] = x60; GU[61 * 128 + c] = x61; GU[62 * 128 + c] = x62; GU[63 * 128 + c] = x63; }
        else { GNW[0 * 128 + (c - 128)] = (bf16)f2bf(-x0); GNW[1 * 128 + (c - 128)] = (bf16)f2bf(-x1); GNW[2 * 128 + (c - 128)] = (bf16)f2bf(-x2); GNW[3 * 128 + (c - 128)] = (bf16)f2bf(-x3); GNW[4 * 128 + (c - 128)] = (bf16)f2bf(-x4); GNW[5 * 128 + (c - 128)] = (bf16)f2bf(-x5); GNW[6 * 128 + (c - 128)] = (bf16)f2bf(-x6); GNW[7 * 128 + (c - 128)] = (bf16)f2bf(-x7); GNW[8 * 128 + (c - 128)] = (bf16)f2bf(-x8); GNW[9 * 128 + (c - 128)] = (bf16)f2bf(-x9); GNW[10 * 128 + (c - 128)] = (bf16)f2bf(-x10); GNW[11 * 128 + (c - 128)] = (bf16)f2bf(-x11); GNW[12 * 128 + (c - 128)] = (bf16)f2bf(-x12); GNW[13 * 128 + (c - 128)] = (bf16)f2bf(-x13); GNW[14 * 128 + (c - 128)] = (bf16)f2bf(-x14); GNW[15 * 128 + (c - 128)] = (bf16)f2bf(-x15); GNW[16 * 128 + (c - 128)] = (bf16)f2bf(-x16); GNW[17 * 128 + (c - 128)] = (bf16)f2bf(-x17); GNW[18 * 128 + (c - 128)] = (bf16)f2bf(-x18); GNW[19 * 128 + (c - 128)] = (bf16)f2bf(-x19); GNW[20 * 128 + (c - 128)] = (bf16)f2bf(-x20); GNW[21 * 128 + (c - 128)] = (bf16)f2bf(-x21); GNW[22 * 128 + (c - 128)] = (bf16)f2bf(-x22); GNW[23 * 128 + (c - 128)] = (bf16)f2bf(-x23); GNW[24 * 128 + (c - 128)] = (bf16)f2bf(-x24); GNW[25 * 128 + (c - 128)] = (bf16)f2bf(-x25); GNW[26 * 128 + (c - 128)] = (bf16)f2bf(-x26); GNW[27 * 128 + (c - 128)] = (bf16)f2bf(-x27); GNW[28 * 128 + (c - 128)] = (bf16)f2bf(-x28); GNW[29 * 128 + (c - 128)] = (bf16)f2bf(-x29); GNW[30 * 128 + (c - 128)] = (bf16)f2bf(-x30); GNW[31 * 128 + (c - 128)] = (bf16)f2bf(-x31); GNW[32 * 128 + (c - 128)] = (bf16)f2bf(-x32); GNW[33 * 128 + (c - 128)] = (bf16)f2bf(-x33); GNW[34 * 128 + (c - 128)] = (bf16)f2bf(-x34); GNW[35 * 128 + (c - 128)] = (bf16)f2bf(-x35); GNW[36 * 128 + (c - 128)] = (bf16)f2bf(-x36); GNW[37 * 128 + (c - 128)] = (bf16)f2bf(-x37); GNW[38 * 128 + (c - 128)] = (bf16)f2bf(-x38); GNW[39 * 128 + (c - 128)] = (bf16)f2bf(-x39); GNW[40 * 128 + (c - 128)] = (bf16)f2bf(-x40); GNW[41 * 128 + (c - 128)] = (bf16)f2bf(-x41); GNW[42 * 128 + (c - 128)] = (bf16)f2bf(-x42); GNW[43 * 128 + (c - 128)] = (bf16)f2bf(-x43); GNW[44 * 128 + (c - 128)] = (bf16)f2bf(-x44); GNW[45 * 128 + (c - 128)] = (bf16)f2bf(-x45); GNW[46 * 128 + (c - 128)] = (bf16)f2bf(-x46); GNW[47 * 128 + (c - 128)] = (bf16)f2bf(-x47); GNW[48 * 128 + (c - 128)] = (bf16)f2bf(-x48); GNW[49 * 128 + (c - 128)] = (bf16)f2bf(-x49); GNW[50 * 128 + (c - 128)] = (bf16)f2bf(-x50); GNW[51 * 128 + (c - 128)] = (bf16)f2bf(-x51); GNW[52 * 128 + (c - 128)] = (bf16)f2bf(-x52); GNW[53 * 128 + (c - 128)] = (bf16)f2bf(-x53); GNW[54 * 128 + (c - 128)] = (bf16)f2bf(-x54); GNW[55 * 128 + (c - 128)] = (bf16)f2bf(-x55); GNW[56 * 128 + (c - 128)] = (bf16)f2bf(-x56); GNW[57 * 128 + (c - 128)] = (bf16)f2bf(-x57); GNW[58 * 128 + (c - 128)] = (bf16)f2bf(-x58); GNW[59 * 128 + (c - 128)] = (bf16)f2bf(-x59); GNW[60 * 128 + (c - 128)] = (bf16)f2bf(-x60); GNW[61 * 128 + (c - 128)] = (bf16)f2bf(-x61); GNW[62 * 128 + (c - 128)] = (bf16)f2bf(-x62); GNW[63 * 128 + (c - 128)] = (bf16)f2bf(-x63); }
#undef GDN_RHS
#undef GDN_L4
    } else {
        const int t2 = tid - 256; const float gl = gcs[63];
        { const int i = t2 >> 2, d0 = (t2 & 3) * 32; const float e = __expf(gcs[i]);
#pragma unroll
          for (int x8 = 0; x8 < 4; ++x8) { const v4f a = *(const LAS v4f*)(qs + i * QP + d0 + 8 * x8), b = *(const LAS v4f*)(qs + i * QP + d0 + 8 * x8 + 4);
              v4u w; w.x = pk2(a.x * e, a.y * e); w.y = pk2(a.z * e, a.w * e); w.z = pk2(b.x * e, b.y * e); w.w = pk2(b.z * e, b.w * e); *(v4u*)(GQG + i * 128 + d0 + 8 * x8) = w; } }
        { const int d = t2 >> 1, j0 = (t2 & 1) * 32;
#pragma unroll
          for (int x8 = 0; x8 < 4; ++x8) { float o[8];
#pragma unroll
              for (int x = 0; x < 8; ++x) { const int j = j0 + 8 * x8 + x; o[x] = ks[j * QP + d] * __expf(gl - gcs[j]); }
              v4u w; w.x = pk2(o[0], o[1]); w.y = pk2(o[2], o[3]); w.z = pk2(o[4], o[5]); w.w = pk2(o[6], o[7]); *(v4u*)(GKT + d * 64 + j0 + 8 * x8) = w; } }
        if (t2 == 0) GDL[item] = __expf(gl);
    }
    __syncthreads();
}
struct GdnFrags { bf16x8_t nw[4], qg[4], at[2], kt[2][2]; float u[4]; float dl; };
__device__ __forceinline__ void gdn_load(GdnFrags& F, const Params& p, int item, int off128, int off64, int offk, int offu) {
    const bf16* GNW = (const bf16*)(p.ws + WS_GNW) + (size_t)item * 8192; const bf16* GQG = (const bf16*)(p.ws + WS_GQG) + (size_t)item * 8192;
    const bf16* GAT = (const bf16*)(p.ws + WS_GAT) + (size_t)item * 4096; const bf16* GKT = (const bf16*)(p.ws + WS_GKT) + (size_t)item * 8192; const float* GU = (const float*)(p.ws + WS_GU) + (size_t)item * 8192;
#pragma unroll
    for (int ks = 0; ks < 4; ++ks) { F.nw[ks] = *(const bf16x8_t*)(GNW + off128 + 32 * ks); F.qg[ks] = *(const bf16x8_t*)(GQG + off128 + 32 * ks); }
#pragma unroll
    for (int ks = 0; ks < 2; ++ks) { F.at[ks] = *(const bf16x8_t*)(GAT + off64 + 32 * ks); F.kt[0][ks] = *(const bf16x8_t*)(GKT + offk + 32 * ks); F.kt[1][ks] = *(const bf16x8_t*)(GKT + offk + 1024 + 32 * ks); }
#pragma unroll
    for (int r = 0; r < 4; ++r) F.u[r] = GU[offu + r * 128];
    F.dl = ((const float*)(p.ws + WS_GDL))[item];
}
constexpr int STP = 136, VNP = 72;
__device__ __forceinline__ void gdn_seq(const Params& p, LAS unsigned char* lds, int wgi, int wave, int lane) {
    const int u = wgi * 2 + (wave >> 2), wi = wave & 3, h = u >> 3, sl = u & 7, g = lane >> 4, c = lane & 15;
    LAS unsigned short* ST = (LAS unsigned short*)(lds + (wave >> 2) * 12288);
    LAS unsigned short* VNT = ST + 2 * 16 * STP;
    float* GO = (float*)(p.ws + WS_GO);
    const int off128 = (16 * wi + c) * 128 + 8 * g, off64 = (16 * wi + c) * 64 + 8 * g, offk = (32 * wi + c) * 64 + 8 * g, offu = (16 * wi + 4 * g) * 128 + 16 * sl + c;
#pragma unroll
    for (int mt = 0; mt < 2; ++mt) *(LAS v2u*)(ST + c * STP + 16 * (2 * wi + mt) + 4 * g) = (v2u){0u, 0u};
    pg8::f32x4 Sacc[2] = {{0.f, 0.f, 0.f, 0.f}, {0.f, 0.f, 0.f, 0.f}};
    __syncthreads();
    GdnFrags F0, F1;
    gdn_load(F0, p, h, off128, off64, offk, offu);
#define GDN_STEP(F, n_) do { const int cur = (n_) & 1; bf16x8_t sf[4]; \
        _Pragma("unroll") for (int ks = 0; ks < 4; ++ks) sf[ks] = *(const LAS bf16x8_t*)(ST + cur * 16 * STP + c * STP + 32 * ks + 8 * g); \
        pg8::f32x4 vn = {F.u[0], F.u[1], F.u[2], F.u[3]}; \
        _Pragma("unroll") for (int ks = 0; ks < 4; ++ks) vn = __builtin_amdgcn_mfma_f32_16x16x32_bf16(F.nw[ks], sf[ks], vn, 0, 0, 0); \
        { v2u w; w.x = pk2(vn[0], vn[1]); w.y = pk2(vn[2], vn[3]); *(LAS v2u*)(VNT + c * VNP + 16 * wi + 4 * g) = w; } \
        LDS_BAR(); \
        const bf16x8_t v0 = *(const LAS bf16x8_t*)(VNT + c * VNP + 8 * g), v1 = *(const LAS bf16x8_t*)(VNT + c * VNP + 32 + 8 * g); \
        pg8::f32x4 o = {0.f, 0.f, 0.f, 0.f}; \
        _Pragma("unroll") for (int ks = 0; ks < 4; ++ks) o = __builtin_amdgcn_mfma_f32_16x16x32_bf16(F.qg[ks], sf[ks], o, 0, 0, 0); \
        o = __builtin_amdgcn_mfma_f32_16x16x32_bf16(F.at[0], v0, o, 0, 0, 0); o = __builtin_amdgcn_mfma_f32_16x16x32_bf16(F.at[1], v1, o, 0, 0, 0); \
        { const size_t tb = (size_t)(n_) * 64 + 16 * wi + 4 * g; _Pragma("unroll") for (int r = 0; r < 4; ++r) GO[(tb + r) * BW + h * 128 + 16 * sl + c] = o[r]; } \
        _Pragma("unroll") for (int mt = 0; mt < 2; ++mt) { Sacc[mt] = Sacc[mt] * F.dl; \
            Sacc[mt] = __builtin_amdgcn_mfma_f32_16x16x32_bf16(F.kt[mt][0], v0, Sacc[mt], 0, 0, 0); Sacc[mt] = __builtin_amdgcn_mfma_f32_16x16x32_bf16(F.kt[mt][1], v1, Sacc[mt], 0, 0, 0); \
            v2u w; w.x = pk2(Sacc[mt][0], Sacc[mt][1]); w.y = pk2(Sacc[mt][2], Sacc[mt][3]); *(LAS v2u*)(ST + (cur ^ 1) * 16 * STP + c * STP + 16 * (2 * wi + mt) + 4 * g) = w; } \
        LDS_BAR(); } while (0)
    for (int n = 0; n < T / 64; n += 2) {
        gdn_load(F1, p, (n + 1) * 4 + h, off128, off64, offk, offu);
        GDN_STEP(F0, n);
        gdn_load(F0, p, ((n + 2 < T / 64) ? n + 2 : n) * 4 + h, off128, off64, offk, offu);
        GDN_STEP(F1, n + 1);
    }
#undef GDN_STEP
}

constexpr int SEQ_UOFF = 132096;
constexpr int GI_NW = 0, GI_QG = 8704, GI_AT = 17408, GI_KT = 22016, GI_SZ = 31232;
struct GdnStage { v4u r[7]; float u[4]; float dl; };
__device__ __forceinline__ void gdn_stage_load(GdnStage& Sg, const Params& p, int item, int tid, int offu) {
    const bf16* GNW = (const bf16*)(p.ws + WS_GNW) + (size_t)item * 8192; const bf16* GQG = (const bf16*)(p.ws + WS_GQG) + (size_t)item * 8192;
    const bf16* GAT = (const bf16*)(p.ws + WS_GAT) + (size_t)item * 4096; const bf16* GKT = (const bf16*)(p.ws + WS_GKT) + (size_t)item * 8192; const float* GU = (const float*)(p.ws + WS_GU) + (size_t)item * 8192;
    Sg.r[0] = *(const v4u*)(GNW + 8 * tid); Sg.r[1] = *(const v4u*)(GNW + 8 * (tid + 512)); Sg.r[2] = *(const v4u*)(GQG + 8 * tid); Sg.r[3] = *(const v4u*)(GQG + 8 * (tid + 512));
    Sg.r[4] = *(const v4u*)(GAT + 8 * tid); Sg.r[5] = *(const v4u*)(GKT + 8 * tid); Sg.r[6] = *(const v4u*)(GKT + 8 * (tid + 512));
#pragma unroll
    for (int r = 0; r < 4; ++r) Sg.u[r] = GU[offu + r * 128];
    Sg.dl = ((const float*)(p.ws + WS_GDL))[item];
}
__device__ __forceinline__ void gdn_stage_write(const GdnStage& Sg, LAS unsigned short* img, int tid) {
    { const int p0 = tid, p1 = tid + 512;
      *(LAS v4u*)(img + GI_NW + (p0 >> 4) * 136 + 8 * (p0 & 15)) = Sg.r[0]; *(LAS v4u*)(img + GI_NW + (p1 >> 4) * 136 + 8 * (p1 & 15)) = Sg.r[1];
      *(LAS v4u*)(img + GI_QG + (p0 >> 4) * 136 + 8 * (p0 & 15)) = Sg.r[2]; *(LAS v4u*)(img + GI_QG + (p1 >> 4) * 136 + 8 * (p1 & 15)) = Sg.r[3];
      *(LAS v4u*)(img + GI_AT + (p0 >> 3) * 72 + 8 * (p0 & 7)) = Sg.r[4];
      *(LAS v4u*)(img + GI_KT + (p0 >> 3) * 72 + 8 * (p0 & 7)) = Sg.r[5]; *(LAS v4u*)(img + GI_KT + (p1 >> 3) * 72 + 8 * (p1 & 7)) = Sg.r[6]; }
}
__device__ __forceinline__ void gdn_seq2(const Params& p, LAS unsigned char* lds, int wgi, int tid, int wave, int lane) {
    const int h = wgi >> 2, sl = 2 * (wgi & 3) + (wave >> 2), wi = wave & 3, g = lane >> 4, c = lane & 15;
    LAS unsigned short* IMG = (LAS unsigned short*)lds;
    LAS unsigned short* ST = (LAS unsigned short*)(lds + SEQ_UOFF + (wave >> 2) * 12288);
    LAS unsigned short* VNT = ST + 2 * 16 * STP;
    float* GO = (float*)(p.ws + WS_GO);
    const int offu = (16 * wi + 4 * g) * 128 + 16 * sl + c;
#pragma unroll
    for (int mt = 0; mt < 2; ++mt) *(LAS v2u*)(ST + c * STP + 16 * (2 * wi + mt) + 4 * g) = (v2u){0u, 0u};
    pg8::f32x4 Sacc[2] = {{0.f, 0.f, 0.f, 0.f}, {0.f, 0.f, 0.f, 0.f}};
    GdnStage A, B;
    gdn_stage_load(A, p, h, tid, offu); gdn_stage_write(A, IMG, tid);
    gdn_stage_load(B, p, 4 + h, tid, offu);
    LDS_BAR();
    constexpr int NCH = T / 64;
#define GDN_STEP2(X, Y, n_) do { const int cur = (n_) & 1; const LAS unsigned short* im = IMG + cur * GI_SZ; bf16x8_t sf[4]; \
        _Pragma("unroll") for (int ks = 0; ks < 4; ++ks) sf[ks] = *(const LAS bf16x8_t*)(ST + cur * 16 * STP + c * STP + 32 * ks + 8 * g); \
        pg8::f32x4 vn = {X.u[0], X.u[1], X.u[2], X.u[3]}; const float dl = X.dl; \
        _Pragma("unroll") for (int ks = 0; ks < 4; ++ks) vn = __builtin_amdgcn_mfma_f32_16x16x32_bf16(*(const LAS bf16x8_t*)(im + GI_NW + (16 * wi + c) * 136 + 32 * ks + 8 * g), sf[ks], vn, 0, 0, 0); \
        { v2u w; w.x = pk2(vn[0], vn[1]); w.y = pk2(vn[2], vn[3]); *(LAS v2u*)(VNT + c * VNP + 16 * wi + 4 * g) = w; } \
        pg8::f32x4 o = {0.f, 0.f, 0.f, 0.f}; \
        _Pragma("unroll") for (int ks = 0; ks < 4; ++ks) o = __builtin_amdgcn_mfma_f32_16x16x32_bf16(*(const LAS bf16x8_t*)(im + GI_QG + (16 * wi + c) * 136 + 32 * ks + 8 * g), sf[ks], o, 0, 0, 0); \
        LDS_BAR(); \
        gdn_stage_load(X, p, (((n_) + 2 < NCH) ? (n_) + 2 : (n_)) * 4 + h, tid, offu); \
        const bf16x8_t v0 = *(const LAS bf16x8_t*)(VNT + c * VNP + 8 * g), v1 = *(const LAS bf16x8_t*)(VNT + c * VNP + 32 + 8 * g); \
        o = __builtin_amdgcn_mfma_f32_16x16x32_bf16(*(const LAS bf16x8_t*)(im + GI_AT + (16 * wi + c) * 72 + 8 * g), v0, o, 0, 0, 0); \
        o = __builtin_amdgcn_mfma_f32_16x16x32_bf16(*(const LAS bf16x8_t*)(im + GI_AT + (16 * wi + c) * 72 + 32 + 8 * g), v1, o, 0, 0, 0); \
        { const size_t tb = (size_t)(n_) * 64 + 16 * wi + 4 * g; _Pragma("unroll") for (int r = 0; r < 4; ++r) GO[(tb + r) * BW + h * 128 + 16 * sl + c] = o[r]; } \
        _Pragma("unroll") for (int mt = 0; mt < 2; ++mt) { Sacc[mt] = Sacc[mt] * dl; \
            Sacc[mt] = __builtin_amdgcn_mfma_f32_16x16x32_bf16(*(const LAS bf16x8_t*)(im + GI_KT + (16 * (2 * wi + mt) + c) * 72 + 8 * g), v0, Sacc[mt], 0, 0, 0); \
            Sacc[mt] = __builtin_amdgcn_mfma_f32_16x16x32_bf16(*(const LAS bf16x8_t*)(im + GI_KT + (16 * (2 * wi + mt) + c) * 72 + 32 + 8 * g), v1, Sacc[mt], 0, 0, 0); \
            v2u w; w.x = pk2(Sacc[mt][0], Sacc[mt][1]); w.y = pk2(Sacc[mt][2], Sacc[mt][3]); *(LAS v2u*)(ST + (cur ^ 1) * 16 * STP + c * STP + 16 * (2 * wi + mt) + 4 * g) = w; } \
        gdn_stage_write(Y, IMG + (cur ^ 1) * GI_SZ, tid); \
        LDS_BAR(); } while (0)
    for (int n = 0; n < NCH; n += 2) { GDN_STEP2(A, B, n); GDN_STEP2(B, A, n + 1); }
#undef GDN_STEP2
}
constexpr int MI_Q = 0, MI_S = 4608, MI_K = 9216, MI_SZ = 13824;
struct MlStage { v4u r[3]; bf16x8_t vt[2]; float fl; };
__device__ __forceinline__ void ml_stage_load(MlStage& Sg, const Params& p, int item, int tid, int offV) {
    const bf16* MQ = (const bf16*)(p.ws + WS_MQ) + (size_t)item * 4096; const bf16* MS = (const bf16*)(p.ws + WS_MS) + (size_t)item * 4096; const bf16* MK = (const bf16*)(p.ws + WS_MK) + (size_t)item * 4096;
    const bf16* MV = (const bf16*)(p.ws + WS_MV) + (size_t)item * 9216;
    Sg.r[0] = *(const v4u*)(MQ + 8 * tid); Sg.r[1] = *(const v4u*)(MS + 8 * tid); Sg.r[2] = *(const v4u*)(MK + 8 * tid);
    Sg.vt[0] = *(const bf16x8_t*)(MV + offV); Sg.vt[1] = *(const bf16x8_t*)(MV + offV + 32);
    Sg.fl = ((const float*)(p.ws + WS_MFL))[item];
}
__device__ __forceinline__ void ml_stage_write(const MlStage& Sg, LAS unsigned short* img, int tid) {
    const int o = (tid >> 3) * 72 + 8 * (tid & 7);
    *(LAS v4u*)(img + MI_Q + o) = Sg.r[0]; *(LAS v4u*)(img + MI_S + o) = Sg.r[1]; *(LAS v4u*)(img + MI_K + o) = Sg.r[2];
}
__device__ __forceinline__ void ml_seq2(const Params& p, LAS unsigned char* lds, int wgi, int tid, int wave, int lane) {
    const int h = wgi / 5, sl0 = 2 * (wgi % 5) + (wave >> 2), wi = wave & 3, g = lane >> 4, c = lane & 15;
    const bool real = sl0 < 9; const int sl = real ? sl0 : 8;
    LAS unsigned short* IMG = (LAS unsigned short*)lds;
    LAS unsigned short* CT = (LAS unsigned short*)(lds + SEQ_UOFF + (wave >> 2) * 8192);
    float* HO = (float*)(p.ws + WS_HO); float* HDEN = (float*)(p.ws + WS_HDEN);
    const int offV = (16 * sl + c) * 64 + 8 * g;
    *(LAS v2u*)(CT + c * 72 + 16 * wi + 4 * g) = (v2u){0u, 0u};
    pg8::f32x4 Cacc = {0.f, 0.f, 0.f, 0.f};
    MlStage A, B;
    ml_stage_load(A, p, h, tid, offV); ml_stage_write(A, IMG, tid);
    ml_stage_load(B, p, 4 + h, tid, offV);
    LDS_BAR();
    constexpr int NCH = T / 64;
#define ML_STEP2(X, Y, n_) do { const int cur = (n_) & 1; const LAS unsigned short* im = IMG + cur * MI_SZ; const int ro = (16 * wi + c) * 72 + 8 * g; \
        const bf16x8_t c0 = *(const LAS bf16x8_t*)(CT + cur * 16 * 72 + c * 72 + 8 * g), c1 = *(const LAS bf16x8_t*)(CT + cur * 16 * 72 + c * 72 + 32 + 8 * g); \
        const bf16x8_t vt0 = X.vt[0], vt1 = X.vt[1]; const float fl = X.fl; \
        pg8::f32x4 num = {0.f, 0.f, 0.f, 0.f}; \
        num = __builtin_amdgcn_mfma_f32_16x16x32_bf16(*(const LAS bf16x8_t*)(im + MI_Q + ro), c0, num, 0, 0, 0); num = __builtin_amdgcn_mfma_f32_16x16x32_bf16(*(const LAS bf16x8_t*)(im + MI_Q + ro + 32), c1, num, 0, 0, 0); \
        num = __builtin_amdgcn_mfma_f32_16x16x32_bf16(*(const LAS bf16x8_t*)(im + MI_S + ro), vt0, num, 0, 0, 0); num = __builtin_amdgcn_mfma_f32_16x16x32_bf16(*(const LAS bf16x8_t*)(im + MI_S + ro + 32), vt1, num, 0, 0, 0); \
        Cacc = Cacc * fl; \
        Cacc = __builtin_amdgcn_mfma_f32_16x16x32_bf16(*(const LAS bf16x8_t*)(im + MI_K + ro), vt0, Cacc, 0, 0, 0); Cacc = __builtin_amdgcn_mfma_f32_16x16x32_bf16(*(const LAS bf16x8_t*)(im + MI_K + ro + 32), vt1, Cacc, 0, 0, 0); \
        ml_stage_load(X, p, (((n_) + 2 < NCH) ? (n_) + 2 : (n_)) * 4 + h, tid, offV); \
        { v2u w; w.x = pk2(Cacc[0], Cacc[1]); w.y = pk2(Cacc[2], Cacc[3]); *(LAS v2u*)(CT + (cur ^ 1) * 16 * 72 + c * 72 + 16 * wi + 4 * g) = w; } \
        { const size_t tb = (size_t)(n_) * 64 + 16 * wi + 4 * g; \
          if (sl < 8) { _Pragma("unroll") for (int r = 0; r < 4; ++r) HO[(tb + r) * BW + h * 128 + 16 * sl + c] = num[r]; } \
          else if (c == 0 && real) { _Pragma("unroll") for (int r = 0; r < 4; ++r) HDEN[(tb + r) * 4 + h] = num[r]; } } \
        ml_stage_write(Y, IMG + (cur ^ 1) * MI_SZ, tid); \
        LDS_BAR(); } while (0)
    for (int n = 0; n < NCH; n += 2) { ML_STEP2(A, B, n); ML_STEP2(B, A, n + 1); }
#undef ML_STEP2
}

__device__ __forceinline__ void mixer_gmlp_item(const Params& p, int l, LAS unsigned char* lds, int item, int tid, int wave, int lane) {
    const int chunk = item >> 2, g = item & 3; const size_t tok0 = (size_t)chunk * 128;
    const bf16* Z = (const bf16*)(p.ws + WS_Z); bf16* BR1 = (bf16*)(p.ws + WS_BR) + 1 * BW;
    const float* ng = p.in[I_GMNG] + l * BW; const float* nb = p.in[I_GMNB] + l * BW;
    const float* wsp = p.in[I_GMWS] + ((size_t)(l * 4 + g) * 128) * 128; const float* bsp = p.in[I_GMBS] + (l * 4 + g) * 128;
    LAS float* vn = (LAS float*)lds;
    for (int r = 0; r < 16; ++r) { const int tk = wave * 16 + r;
        const v4u raw = *(const v4u*)(Z + (tok0 + tk) * ZC + ZC_GMV + 8 * lane); float x[8]; unpack8(raw, x); float s = 0.f;
#pragma unroll
        for (int i = 0; i < 8; ++i) { x[i] = gelu_tanh(x[i]); s += x[i]; }
        const float mean = wave_sum(s) * (1.f / 512.f); float ss = 0.f;
#pragma unroll
        for (int i = 0; i < 8; ++i) { x[i] -= mean; ss += x[i] * x[i]; }
        const float rstd = rsqrtf(wave_sum(ss) * (1.f / 512.f) + LN_EPS);
        if ((lane >> 4) == g) { const int cl = 8 * (lane & 15);
#pragma unroll
            for (int i = 0; i < 8; ++i) vn[tk * 128 + cl + i] = x[i] * rstd * ng[8 * lane + i] + nb[8 * lane + i]; }
    }
    __syncthreads();
    const int t = tid >> 2, cq = tid & 3; float acc[32];
#pragma unroll
    for (int i = 0; i < 32; ++i) acc[i] = 0.f;
    const float* wrow = wsp + (size_t)t * 128;
    for (int s = 0; s <= t; ++s) { const float w = wrow[s]; const LAS float* row = vn + s * 128 + cq * 32;
#pragma unroll
        for (int i4 = 0; i4 < 8; ++i4) { const v4f a = *(const LAS v4f*)(row + 4 * i4); acc[4 * i4] += w * a.x; acc[4 * i4 + 1] += w * a.y; acc[4 * i4 + 2] += w * a.z; acc[4 * i4 + 3] += w * a.w; } }
    const float bias = bsp[t];
#pragma unroll
    for (int i8 = 0; i8 < 4; ++i8) { const v4u raw = *(const v4u*)(Z + (tok0 + t) * ZC + ZC_GMU + g * 128 + cq * 32 + 8 * i8); float u[8]; unpack8(raw, u); float o[8];
#pragma unroll
        for (int i = 0; i < 8; ++i) o[i] = gelu_tanh(u[i]) * (acc[8 * i8 + i] + bias);
#if MERGE_FP8
        *(v2u*)((unsigned char*)(p.ws + WS_BR) + (tok0 + t) * BRW + 1 * BW + g * 128 + cq * 32 + 8 * i8) = (v2u){pk4_f8(o[0], o[1], o[2], o[3], BRSC), pk4_f8(o[4], o[5], o[6], o[7], BRSC)}; }
#else
        v4u w; w.x = pk2(o[0], o[1]); w.y = pk2(o[2], o[3]); w.z = pk2(o[4], o[5]); w.w = pk2(o[6], o[7]);
        *(v4u*)(BR1 + (tok0 + t) * BRW + g * 128 + cq * 32 + 8 * i8) = w; }
#endif
    __syncthreads();
}

__device__ __forceinline__ void vt_item(const Params& p, LAS unsigned char* lds, int item, int tid) {
    const int h = item & 3, n = item >> 2; const size_t t0 = (size_t)n * 64;
    const bf16* Z = (const bf16*)(p.ws + WS_Z); bf16* VT = (bf16*)(p.ws + WS_VT);
    LAS unsigned short* vs = (LAS unsigned short*)lds;
#pragma unroll
    for (int r = 0; r < 2; ++r) { const int idx = tid + 512 * r, tk = idx >> 4, c8 = idx & 15;
        *(LAS v4u*)(vs + tk * 136 + 8 * c8) = *(const v4u*)(Z + (t0 + tk) * ZC + ZC_SBV + h * 128 + 8 * c8); }
    __syncthreads();
    { const int d = tid >> 2, jq = tid & 3; unsigned w[8];
#pragma unroll
      for (int x = 0; x < 8; ++x) w[x] = (unsigned)vs[(16 * jq + 2 * x) * 136 + d] | ((unsigned)vs[(16 * jq + 2 * x + 1) * 136 + d] << 16);
      bf16* dst = VT + ((size_t)h * 128 + d) * T + t0 + 16 * jq;
      *(v4u*)dst = (v4u){w[0], w[1], w[2], w[3]}; *(v4u*)(dst + 8) = (v4u){w[4], w[5], w[6], w[7]}; }
    __syncthreads();
}
constexpr int KTP = 136, VTP = 72;
__device__ __forceinline__ void sb_unit(const Params& p, LAS unsigned char* lds, int unit, int tid, int wave, int lane) {
    const int h = unit >> 6, q0 = (unit & 63) * 128, g = lane >> 4, c = lane & 15; const int qrow = q0 + 16 * wave + c;
    const bf16* Z = (const bf16*)(p.ws + WS_Z); const bf16* VT = (const bf16*)(p.ws + WS_VT) + (size_t)h * 128 * T; bf16* BR0 = (bf16*)(p.ws + WS_BR);
    LAS unsigned short* Kt = (LAS unsigned short*)lds;
    LAS unsigned short* Vt = Kt + 2 * 64 * KTP;
    LAS int* flags = (LAS int*)(Vt + 2 * 128 * VTP);
    bf16x8_t qf[4];
#pragma unroll
    for (int ks = 0; ks < 4; ++ks) qf[ks] = *(const bf16x8_t*)(Z + (size_t)qrow * ZC + ZC_SBQ + h * 128 + 32 * ks + 8 * g);
    pg8::f32x4 acc[8];
#pragma unroll
    for (int dt = 0; dt < 8; ++dt) acc[dt] = (pg8::f32x4){0.f, 0.f, 0.f, 0.f};
    float racc = 0.f;
    v4u kr[2], vr[2];
    const int jt = (q0 >> 6) + 1;
#define SB_GLOAD(j_) do { _Pragma("unroll") for (int r = 0; r < 2; ++r) { const int idx = tid + 512 * r; \
        kr[r] = *(const v4u*)(Z + (size_t)(64 * (j_) + (idx >> 4)) * ZC + ZC_SBK + h * 128 + 8 * (idx & 15)); \
        vr[r] = *(const v4u*)(VT + (size_t)(idx >> 3) * T + 64 * (j_) + 8 * (idx & 7)); } } while (0)
#define SB_LWRITE(b_) do { _Pragma("unroll") for (int r = 0; r < 2; ++r) { const int idx = tid + 512 * r; \
        *(LAS v4u*)(Kt + (b_) * 64 * KTP + (idx >> 4) * KTP + 8 * (idx & 15)) = kr[r]; *(LAS v4u*)(Vt + (b_) * 128 * VTP + (idx >> 3) * VTP + 8 * (idx & 7)) = vr[r]; } } while (0)
    LDS_BAR();
    SB_GLOAD(jt); SB_LWRITE(0);
    LDS_BAR();
    for (int j = jt, it = 0; j >= 0; --j, ++it) {
        const int cur = it & 1;
        SB_GLOAD(j > 0 ? j - 1 : 0);
        const bool wdone = __all(racc > 104.f);
        if (64 * j < q0 + 16 * wave + 15 && !wdone) {
            const LAS unsigned short* Kc = Kt + cur * 64 * KTP; const LAS unsigned short* Vc = Vt + cur * 128 * VTP;
            pg8::f32x4 z[4];
#pragma unroll
            for (int s = 0; s < 4; ++s) { z[s] = (pg8::f32x4){0.f, 0.f, 0.f, 0.f};
#pragma unroll
                for (int ks = 0; ks < 4; ++ks) z[s] = __builtin_amdgcn_mfma_f32_16x16x32_bf16(*(const LAS bf16x8_t*)(Kc + (16 * s + c) * KTP + 32 * ks + 8 * g), qf[ks], z[s], 0, 0, 0); }
            float sp[4][4], t[4], xs[4]; bool mk[4][4];
#pragma unroll
            for (int s = 0; s < 4; ++s) { t[s] = 0.f;
#pragma unroll
                for (int r = 0; r < 4; ++r) { const int key = 64 * j + 16 * s + 4 * g + r; mk[s][r] = key < qrow; const float zz = z[s][r] * 0.08838834764831845f; z[s][r] = zz;
                    sp[s][r] = mk[s][r] ? softplusf_(zz) : 0.f; t[s] += sp[s][r]; } }
            float grand = 0.f, higher[4];
#pragma unroll
            for (int s = 3; s >= 0; --s) { float x = t[s]; float y = __shfl(x, lane + 16); x += (g < 3) ? y : 0.f; y = __shfl(x, lane + 32); x += (g < 2) ? y : 0.f;
                xs[s] = x - t[s];
                const float tot = __shfl(x, c); higher[s] = grand; grand += tot; }
            bf16x8_t pf[2];
#pragma unroll
            for (int s = 0; s < 4; ++s) { float a[4]; float e = 0.f;
#pragma unroll
                for (int r = 3; r >= 0; --r) { const float la = z[s][r] - sp[s][r] - (racc + higher[s] + xs[s] + e); a[r] = mk[s][r] ? __expf(la) : 0.f; e += sp[s][r]; }
                const unsigned w0 = pk2(a[0], a[1]), w1 = pk2(a[2], a[3]);
                if ((s & 1) == 0) { pf[s >> 1][0] = (short)(w0 & 0xffff); pf[s >> 1][1] = (short)(w0 >> 16); pf[s >> 1][2] = (short)(w1 & 0xffff); pf[s >> 1][3] = (short)(w1 >> 16); }
                else              { pf[s >> 1][4] = (short)(w0 & 0xffff); pf[s >> 1][5] = (short)(w0 >> 16); pf[s >> 1][6] = (short)(w1 & 0xffff); pf[s >> 1][7] = (short)(w1 >> 16); } }
            racc += grand;
#pragma unroll
            for (int dt = 0; dt < 8; ++dt)
#pragma unroll
                for (int k2 = 0; k2 < 2; ++k2) { const v2u lo = *(const LAS v2u*)(Vc + (16 * dt + c) * VTP + 32 * k2 + 4 * g), hi = *(const LAS v2u*)(Vc + (16 * dt + c) * VTP + 32 * k2 + 16 + 4 * g);
                    const v4u vv = (v4u){lo.x, lo.y, hi.x, hi.y};
                    acc[dt] = __builtin_amdgcn_mfma_f32_16x16x32_bf16(__builtin_bit_cast(bf16x8_t, vv), pf[k2], acc[dt], 0, 0, 0); }
        }
        const bool wd2 = __all(racc > 104.f);
        if (lane == 0) flags[cur * 8 + wave] = wd2 ? 1 : 0;
        SB_LWRITE(cur ^ 1);
        LDS_BAR();
        int alld = 1;
#pragma unroll
        for (int w = 0; w < 8; ++w) alld &= flags[cur * 8 + w];
        if (alld) break;
    }
#undef SB_GLOAD
#undef SB_LWRITE
#pragma unroll
#if MERGE_FP8
    for (int dt = 0; dt < 8; ++dt) *(unsigned*)((unsigned char*)BR0 + (size_t)qrow * BRW + h * 128 + 16 * dt + 4 * g) = pk4_f8(acc[dt][0], acc[dt][1], acc[dt][2], acc[dt][3], BRSC);
#else
    for (int dt = 0; dt < 8; ++dt) { v2u w; w.x = pk2(acc[dt][0], acc[dt][1]); w.y = pk2(acc[dt][2], acc[dt][3]); *(v2u*)(BR0 + (size_t)qrow * BRW + h * 128 + 16 * dt + 4 * g) = w; }
#endif
}

__device__ __forceinline__ void phase_mixers(const Params& p, int l, LAS unsigned char* lds, int wg, int G, int tid, int wave, int lane, const XcdBarrier& bar) {
#if defined(PROBE_SPLIT)
    if (wg < 16) gdn_seq2(p, lds, wg, tid, wave, lane); else if (wg < 36) ml_seq2(p, lds, wg - 16, tid, wave, lane);
    xcd_barrier(bar);
    const int w2 = wg, G2 = G;
#else
    if (wg < 16) { gdn_seq2(p, lds, wg, tid, wave, lane); return; }
    if (wg < 36) { ml_seq2(p, lds, wg - 16, tid, wave, lane); return; }
    const int w2 = wg - 36, G2 = G - 36;
#endif
    for (int it = w2; it < 256; it += G2) mixer_gmlp_item(p, l, lds, it, tid, wave, lane);
    for (int it = w2; it < 256; it += G2) sb_unit(p, lds, it, tid, wave, lane);
#if !defined(PROBE_CONV0)
    __syncthreads();
    {
        constexpr int NIT1 = (NEX * 2 * (D / 64) * (ED / 32)) + (NEX * (ED / 64) * (D / 32));
        const int nheavy = (G2 < 256 && 2 * G2 >= 256) ? 256 - G2 : 0, per_wave = NIT1 / (G2 * 8);
        const int NA = (nheavy > 0 && per_wave > 2 * CONV_SKIP) ? (per_wave - CONV_SKIP) * (G2 * 8) : NIT1;
        phase_convert<1>(p, l, lds, w2 * 8 + wave, G2 * 8, wave, lane, false, 0, NA);
        if (NA < NIT1 && w2 >= nheavy) phase_convert<1>(p, l, lds, (w2 - nheavy) * 8 + wave, (G2 - nheavy) * 8, wave, lane, false, NA, NIT1); }
#endif
}

__device__ __forceinline__ void phase_post(const Params& p, int l, int gw, int NGW, int lane) {
    const bf16* Z = (const bf16*)(p.ws + WS_Z); const float* GO = (const float*)(p.ws + WS_GO); const float* HO = (const float*)(p.ws + WS_HO); const float* HDEN = (const float*)(p.ws + WS_HDEN);
    bf16* BR2 = (bf16*)(p.ws + WS_BR) + 2 * BW; bf16* BR3 = (bf16*)(p.ws + WS_BR) + 3 * BW;
    const float* gng = p.in[I_GDNNG] + l * 128; const float* mng = p.in[I_MLNG] + l * BW;
    for (int t = gw; t < T; t += NGW) {
        {   const v4f a0 = *(const v4f*)(GO + (size_t)t * BW + 8 * lane), a1 = *(const v4f*)(GO + (size_t)t * BW + 8 * lane + 4); float o[8] = {a0.x, a0.y, a0.z, a0.w, a1.x, a1.y, a1.z, a1.w}; float ss = 0.f;
#pragma unroll
            for (int i = 0; i < 8; ++i) ss += o[i] * o[i];
            const float r = rsqrtf(sum16(ss) * (1.f / 128.f) + LN_EPS);
            const v4u graw = *(const v4u*)(Z + (size_t)t * ZC + ZC_GDNG + 8 * lane); float gt[8]; unpack8(graw, gt);
#pragma unroll
            for (int i = 0; i < 8; ++i) o[i] = o[i] * r * gng[(8 * lane + i) & 127] * siluf_(gt[i]);
#if MERGE_FP8
            *(v2u*)((unsigned char*)(p.ws + WS_BR) + (size_t)t * BRW + 2 * BW + 8 * lane) = (v2u){pk4_f8(o[0], o[1], o[2], o[3], BRSC), pk4_f8(o[4], o[5], o[6], o[7], BRSC)}; }
#else
            v4u w; w.x = pk2(o[0], o[1]); w.y = pk2(o[2], o[3]); w.z = pk2(o[4], o[5]); w.w = pk2(o[6], o[7]); *(v4u*)(BR2 + (size_t)t * BRW + 8 * lane) = w; }
#endif
        {   const v4f a0 = *(const v4f*)(HO + (size_t)t * BW + 8 * lane), a1 = *(const v4f*)(HO + (size_t)t * BW + 8 * lane + 4); float o[8] = {a0.x, a0.y, a0.z, a0.w, a1.x, a1.y, a1.z, a1.w}; float ss = 0.f;
            const float dn = __builtin_amdgcn_rcpf(fmaxf(fabsf(HDEN[(size_t)t * 4 + (lane >> 4)]), 1.f));
#pragma unroll
            for (int i = 0; i < 8; ++i) { o[i] *= dn; ss += o[i] * o[i]; }
            const float r = rsqrtf(sum16(ss) * (1.f / 128.f) + LN_EPS);
            const v4u graw = *(const v4u*)(Z + (size_t)t * ZC + ZC_MLO + 8 * lane); float gt[8]; unpack8(graw, gt);
#pragma unroll
            for (int i = 0; i < 8; ++i) o[i] = o[i] * r * mng[8 * lane + i] * sigmoidf_(gt[i]);
#if MERGE_FP8
            *(v2u*)((unsigned char*)(p.ws + WS_BR) + (size_t)t * BRW + 3 * BW + 8 * lane) = (v2u){pk4_f8(o[0], o[1], o[2], o[3], BRSC), pk4_f8(o[4], o[5], o[6], o[7], BRSC)}; }
#else
            v4u w; w.x = pk2(o[0], o[1]); w.y = pk2(o[2], o[3]); w.z = pk2(o[4], o[5]); w.w = pk2(o[6], o[7]); *(v4u*)(BR3 + (size_t)t * BRW + 8 * lane) = w; }
#endif
    }
}

__device__ __forceinline__ void ln_row(const float* yrow, const float* g, const float* b, int lane, v4f (&v)[8]) {
    const v4f* yr = (const v4f*)yrow + lane; float s = 0.f;
#pragma unroll
    for (int j = 0; j < 8; ++j) { v[j] = yr[64 * j]; s += (v[j].x + v[j].y) + (v[j].z + v[j].w); }
    const float mean = wave_sum(s) * (1.f / D); float s2 = 0.f;
#pragma unroll
    for (int j = 0; j < 8; ++j) { v[j] = v[j] - mean; s2 += (v[j].x * v[j].x + v[j].y * v[j].y) + (v[j].z * v[j].z + v[j].w * v[j].w); }
    const float rstd = rsqrtf(wave_sum(s2) * (1.f / D) + LN_EPS);
#pragma unroll
    for (int j = 0; j < 8; ++j) { const v4f gg = ((const v4f*)g)[lane + 64 * j], bb = ((const v4f*)b)[lane + 64 * j]; v[j] = v[j] * rstd * gg + bb; }
}
constexpr int RT_XP = 2052;
constexpr int RT_TAB = 131072 + 1024;
__device__ __forceinline__ void phase_ln1_router(const Params& p, int l, LAS unsigned char* lds, int wg, int G, int wave, int lane, int cnt_shift = 0) {
    const bf16* Y = (const bf16*)(p.ws + WS_Y); bf16* X1 = (bf16*)(p.ws + WS_X1); bf16* X1B = (bf16*)(p.ws + WS_X1B); int* LIST = (int*)(p.ws + WS_LIST); float* WL = (float*)(p.ws + WS_WL); unsigned* SLOT = (unsigned*)(p.ws + WS_SLOT);
    unsigned* cnt = (unsigned*)(p.ws + WS_CTL) + CW_CNT + l * 4096 + cnt_shift;
    const float* g1 = p.in[I_LN1G] + (size_t)l * D; const float* b1 = p.in[I_LN1B] + (size_t)l * D;
    const float* wr = p.in[I_WR] + (size_t)l * D * NE; const float rbias = p.in[I_RB][l * NE + lane];
    LAS float* xt = (LAS float*)lds;
    LAS float* part = (LAS float*)lds;
    LAS unsigned char* selm = lds + RT_TAB; LAS unsigned char* rkm = selm + 4096; LAS float* wtm = (LAS float*)(rkm + 4096); LAS unsigned* basem = (LAS unsigned*)(wtm + 4096);
    const int n_l = lane & 15, kq = lane >> 4;
    int gi = 0;
    for (int tg = wg; tg < T / 16; tg += G, ++gi) {
        {   v4f va[8], vb[8]; const size_t m0 = (size_t)tg * 16 + 2 * wave;
#pragma unroll
            for (int j = 0; j < 8; ++j) { va[j] = ld4(Y, m0 * D + 4 * lane + 256 * j, true); vb[j] = ld4(Y, (m0 + 1) * D + 4 * lane + 256 * j, true); }
            float sa = 0.f, sb = 0.f;
#pragma unroll
            for (int j = 0; j < 8; ++j) { sa += (va[j].x + va[j].y) + (va[j].z + va[j].w); sb += (vb[j].x + vb[j].y) + (vb[j].z + vb[j].w); }
            const float ma = wave_sum(sa) * (1.f / D), mb = wave_sum(sb) * (1.f / D); float qa = 0.f, qb = 0.f;
#pragma unroll
            for (int j = 0; j < 8; ++j) { va[j] = va[j] - ma; vb[j] = vb[j] - mb; qa += (va[j].x * va[j].x + va[j].y * va[j].y) + (va[j].z * va[j].z + va[j].w * va[j].w); qb += (vb[j].x * vb[j].x + vb[j].y * vb[j].y) + (vb[j].z * vb[j].z + vb[j].w * vb[j].w); }
            const float ra = rsqrtf(wave_sum(qa) * (1.f / D) + LN_EPS), rb = rsqrtf(wave_sum(qb) * (1.f / D) + LN_EPS);
#pragma unroll
            for (int j = 0; j < 8; ++j) { const v4f gg = ((const v4f*)g1)[lane + 64 * j], bb = ((const v4f*)b1)[lane + 64 * j]; va[j] = va[j] * ra * gg + bb; vb[j] = vb[j] * rb * gg + bb; }
#pragma unroll
            for (int rr = 0; rr < 2; ++rr) { const size_t m = m0 + rr; v2u* xo = (v2u*)(X1 + m * D) + lane;
#pragma unroll
                for (int j = 0; j < 8; ++j) { const v4f v = rr ? vb[j] : va[j]; xo[64 * j] = (v2u){pk2(v.x, v.y), pk2(v.z, v.w)};
#if MOE_UP_FP8
                    { unsigned w = 0; w = __builtin_amdgcn_cvt_pk_fp8_f32(v.x, v.y, w, false); w = __builtin_amdgcn_cvt_pk_fp8_f32(v.z, v.w, w, true); ((unsigned*)((unsigned char*)X1B + m * D))[lane + 64 * j] = w; }
#else
                    { v2u o; o.x = pk2(v.x, v.y); o.y = pk2(v.z, v.w); ((v2u*)(X1B + m * D))[lane + 64 * j] = o; }
#endif
                    *(LAS v4f*)(xt + (2 * wave + rr) * RT_XP + 4 * lane + 256 * j) = v; } } }
        __syncthreads();
        {   pg8::f32x4 acc[4];
#pragma unroll
            for (int i = 0; i < 4; ++i) acc[i] = (pg8::f32x4){0.f, 0.f, 0.f, 0.f};
            const float* wb = wr + (size_t)(256 * wave + 4 * kq) * NE + 4 * n_l;
            const LAS float* xa = xt + n_l * RT_XP + 256 * wave + 4 * kq;
            v4f bwa[16], bwb[16];
#define RT_LOADW(dst, sb_) do { _Pragma("unroll") for (int q = 0; q < 16; ++q) dst[q] = *(const v4f*)(wb + (size_t)(16 * (4 * (sb_) + (q >> 2)) + (q & 3)) * NE); } while (0)
#define RT_MMA(src, sb_) do { _Pragma("unroll") for (int sg = 0; sg < 4; ++sg) { const v4f a4 = *(const LAS v4f*)(xa + 16 * (4 * (sb_) + sg)); \
                _Pragma("unroll") for (int c = 0; c < 4; ++c) { const v4f b4 = src[sg * 4 + c]; const float a = c == 0 ? a4.x : c == 1 ? a4.y : c == 2 ? a4.z : a4.w; \
                    acc[0] = __builtin_amdgcn_mfma_f32_16x16x4f32(a, b4.x, acc[0], 0, 0, 0); acc[1] = __builtin_amdgcn_mfma_f32_16x16x4f32(a, b4.y, acc[1], 0, 0, 0); \
                    acc[2] = __builtin_amdgcn_mfma_f32_16x16x4f32(a, b4.z, acc[2], 0, 0, 0); acc[3] = __builtin_amdgcn_mfma_f32_16x16x4f32(a, b4.w, acc[3], 0, 0, 0); } } } while (0)
            RT_LOADW(bwa, 0);
#pragma unroll 1
            for (int h = 0; h < 2; ++h) {
                RT_LOADW(bwb, 1); RT_MMA(bwa, 0);
                if (h == 0) RT_LOADW(bwa, 2);
                RT_MMA(bwb, 1);
                wb += (size_t)128 * NE; xa += 128; asm volatile("" : "+v"(wb));
            }
#undef RT_LOADW
#undef RT_MMA
            __syncthreads();
#pragma unroll
            for (int j = 0; j < 4; ++j) *(LAS v4f*)(part + (wave * 16 + 4 * kq + j) * 64 + 4 * n_l) = (v4f){acc[0][j], acc[1][j], acc[2][j], acc[3][j]}; }
        __syncthreads();
#pragma unroll 1
        for (int rr = 0; rr < 2; ++rr) { const int lr = wave + 8 * rr; float logit = 0.f;
#pragma unroll
            for (int w = 0; w < 8; ++w) logit += part[(w * 16 + lr) * 64 + lane];
            const float s = sigmoid_div(logit), biased = s + rbias;
            const float m1 = max8(biased); const float li = (float)(lane & 7);
            const float first = min8(biased == m1 ? li : 8.f);
            const float m2 = max8(li == first ? -INFINITY : biased);
            const float gs = m1 + m2; const int myg = lane >> 3; int grank = 0;
#pragma unroll
            for (int g2 = 0; g2 < 8; ++g2) { const float o = __builtin_bit_cast(float, __builtin_amdgcn_readlane(__builtin_bit_cast(int, gs), g2 * 8)); grank += (o > gs || (o == gs && g2 < myg)) ? 1 : 0; }
            const float masked = grank < 4 ? biased : -INFINITY; int rank = 0;
#pragma unroll 8
            for (int e2 = 0; e2 < 64; ++e2) { const float o = __builtin_bit_cast(float, __builtin_amdgcn_readlane(__builtin_bit_cast(int, masked), e2)); rank += (o > masked || (o == masked && e2 < lane)) ? 1 : 0; }
            const float wsel = rank < 6 ? s : 0.f; const float tot = wave_sum(wsel);
            const int ri = gi * 16 + lr;
            selm[ri * 64 + lane] = (rank < 6) ? 1 : 0; rkm[ri * 64 + lane] = (unsigned char)rank; wtm[ri * 64 + lane] = wsel / tot * 2.5f; }
        __syncthreads();
    }
    const int nrows = gi * 16;
    if (wave == 0) { unsigned n = 0;
        for (int r = 0; r < nrows; ++r) n += selm[r * 64 + lane];
        unsigned base = 0; if (n && !(PROBE_NOATOM && cnt_shift)) base = __hip_atomic_fetch_add(cnt + 64 * lane, n, __ATOMIC_RELAXED, __HIP_MEMORY_SCOPE_AGENT);
        basem[lane] = base; }
    __syncthreads();
    for (int ri = wave; ri < nrows; ri += 8) { unsigned pos = basem[lane];
        for (int r = 0; r < ri; ++r) pos += selm[r * 64 + lane];
        if (selm[ri * 64 + lane]) { const size_t m = (size_t)(wg + (ri >> 4) * G) * 16 + (ri & 15); const int rk = rkm[ri * 64 + lane];
            LIST[lane * T + pos] = (int)m; WL[lane * T + pos] = wtm[ri * 64 + lane]; SLOT[m * 8 + rk] = ((unsigned)lane << 16) | pos; } }
    __syncthreads();
}
__device__ __forceinline__ void phase_combine_ln2(const Params& p, int l, void* dst, bool dbf, int gw, int NGW, int lane) {
    const bf16* X1 = (const bf16*)(p.ws + WS_X1); const bf16* YE = (const bf16*)(p.ws + WS_YEXP); const unsigned* SLOT = (const unsigned*)(p.ws + WS_SLOT);
    const unsigned* cnt = (const unsigned*)(p.ws + WS_CTL) + CW_CNT + l * 4096;
    const float* g2 = p.in[I_LN2G] + (size_t)l * D; const float* b2 = p.in[I_LN2B] + (size_t)l * D;
    const int tiles = ((int)cnt[64 * lane] + 255) >> 8; const float incl = wave_scan_incl((float)tiles);
    const int toff = (int)incl - tiles;
    const int tsh = __builtin_amdgcn_readlane((int)incl, 63);
    for (int m = gw; m < T; m += NGW) {
        v4f v[8];
#pragma unroll
        for (int j = 0; j < 8; ++j) v[j] = ld4(X1, (size_t)m * D + 4 * lane + 256 * j, true) * ALPHA;
#pragma unroll
        for (int k = 0; k < 7; ++k) { size_t row;
            if (k == 0) row = (size_t)tsh * 256 + m;
            else { const unsigned s = __builtin_amdgcn_readfirstlane(SLOT[(size_t)m * 8 + (k - 1)]); const int e = (int)(s >> 16); row = (size_t)__builtin_amdgcn_readlane(toff, e) * 256 + (s & 0xffffu); }
#if YEXP_FP8
            const unsigned* yr = (const unsigned*)((const unsigned char*)YE + row * D) + lane;
#pragma unroll
            for (int j = 0; j < 8; ++j) { const unsigned y = yr[64 * j]; const auto lo = __builtin_amdgcn_cvt_pk_f32_fp8(y, false), hi = __builtin_amdgcn_cvt_pk_f32_fp8(y, true);
                v[j].x += lo[0] * (1.f / YSC); v[j].y += lo[1] * (1.f / YSC); v[j].z += hi[0] * (1.f / YSC); v[j].w += hi[1] * (1.f / YSC); } }
#else
            const v2u* yr = (const v2u*)(YE + row * D) + lane;
#pragma unroll
            for (int j = 0; j < 8; ++j) { const v2u y = yr[64 * j]; v[j].x += bflo(y.x); v[j].y += bfhi(y.x); v[j].z += bflo(y.y); v[j].w += bfhi(y.y); } }
#endif
        float s = 0.f;
#pragma unroll
        for (int j = 0; j < 8; ++j) s += (v[j].x + v[j].y) + (v[j].z + v[j].w);
        const float mean = wave_sum(s) * (1.f / D); float s2 = 0.f;
#pragma unroll
        for (int j = 0; j < 8; ++j) { v[j] = v[j] - mean; s2 += (v[j].x * v[j].x + v[j].y * v[j].y) + (v[j].z * v[j].z + v[j].w * v[j].w); }
        const float rstd = rsqrtf(wave_sum(s2) * (1.f / D) + LN_EPS);
#pragma unroll
        for (int j = 0; j < 8; ++j) { const v4f gg = ((const v4f*)g2)[lane + 64 * j], bb = ((const v4f*)b2)[lane + 64 * j]; const v4f o = v[j] * rstd * gg + bb;
            if (dbf) ((v2u*)((bf16*)dst + (size_t)m * D))[lane + 64 * j] = (v2u){pk2(o.x, o.y), pk2(o.z, o.w)};
            else ((v4f*)((float*)dst + (size_t)m * D))[lane + 64 * j] = o; }
    }
}

constexpr int NPH = 11;
template <class S> struct DupOrder {
    S s; int n;
    __device__ __forceinline__ bool next(int i, Unit& u) const { return s.next(i >= n ? i - n : i, u); }
    __device__ __forceinline__ int row_token(int i, int r) const { return s.row_token(i >= n ? i - n : i, r); }
    __device__ __forceinline__ void a_ready(const Unit& u) const { s.a_ready(u); }
    __device__ __forceinline__ void done(const Unit& u) const { s.done(u); }
};
template <class S> __device__ __forceinline__ int count_units(const S& s) { Unit u; int n = 0; while (n < 64 && s.next(n, u)) ++n; return n; }
#define ORDER_T(k, T) typename std::conditional<PROBE_DUP == (k), DupOrder<T>, T>::type
template <class S> __device__ __forceinline__ DupOrder<S> make_order(const S& s, std::true_type) { DupOrder<S> d{s, count_units(s)}; d.n = count_units(s); return d; }
template <class S> __device__ __forceinline__ S make_order(const S& s, std::false_type) { return s; }
#define MAKE_ORDER(k, s) make_order(s, std::integral_constant<bool, PROBE_DUP == (k)>())
template <int l>
__device__ __forceinline__ void run_layer(const Params& p, LAS unsigned char* lds, const XcdBarrier& bar, int tid, int lane, int wave, int G, int wg, int gw, int NGW) {
    unsigned char* ws = p.ws;
    {
        const void* xin = (l == 0) ? (const void*)p.in[I_X] : (const void*)(ws + WS_XCUR);
        void* xout = (l == NL - 1) ? (void*)p.out : (void*)(ws + WS_XCUR);
#ifndef PROBE_DUP
#define PROBE_DUP (-1)
#endif
#define IS_GEMM_PH(k) ((k) == 1 || (k) == 5 || (k) == 6 || (k) == 8 || (k) == 9)
#define REP(k) _Pragma("nounroll") for (int _r = 0; _r < ((PROBE_DUP == (k) && !IS_GEMM_PH(k)) ? 2 + (p.ph_lo >> 20) : 1); ++_r)
#ifndef PH_MASK
#define PH_MASK 0x7ff
#endif
#define RUN(k) (((PH_MASK >> (k)) & 1) && p.ph_lo <= l * NPH + (k) && l * NPH + (k) < p.ph_hi)
#define SEAM(k) do { if (l * NPH + (k) + 1 < p.ph_hi) xcd_barrier(bar); } while (0)
        if (RUN(0)) { REP(0) { phase_convert<0>(p, l, lds, gw, NGW, wave, lane);
#if defined(PROBE_CONV0)
            phase_convert<1>(p, l, lds, gw, NGW, wave, lane);
#endif
 phase_xprep(p, l, xin, l > 0, lds, gw, NGW, tid, lane); } SEAM(0); }
        if (RUN(1)) { REP(1) { pg8::Gemm g{(const bf16*)(ws + WS_XB), (const bf16*)(ws + WS_WIN), T, ZC, D / 2, D / 2, D / 2}; pg8::StaticOrder S; S.init(T, ZC, G, wg);
            pg8::EpiBf16<0> E{(bf16*)(ws + WS_Z), ZC, nullptr, 0, 0, 1.f / 64.f};
            auto S2 = MAKE_ORDER(1, S); pg8::gemm_phase<pg8::EpiBf16<0>, ORDER_T(1, pg8::StaticOrder), true, true, true>(lds, g, S2, E); } SEAM(1); }
        if (RUN(2)) { REP(2) { for (int it = wg; it < 1536; it += G) { if (it < 512) gdn_pre_item(p, l, lds, it, tid, wave, lane); else if (it < 1024) ml_pre_item(p, l, lds, it - 512, tid, wave, lane); else vt_item(p, lds, it - 1024, tid); } } SEAM(2); }
        if (RUN(3)) { REP(3) { phase_mixers(p, l, lds, wg, G, tid, wave, lane, bar); } SEAM(3); }
        if (RUN(4)) { REP(4) { phase_post(p, l, gw, NGW, lane); } SEAM(4); }
        if (RUN(5)) { REP(5) { constexpr int KM = MERGE_FP8 ? BRW / 2 : BRW; pg8::Gemm g{(const bf16*)(ws + WS_BR), (const bf16*)(ws + WS_WBR), T, D, KM, KM, KM}; pg8::StaticOrder S; S.init(T, D, G, wg);
            EpiMergeH E{(const bf16*)(ws + WS_Z), (bf16*)(ws + WS_MSUM)};
            auto S2 = MAKE_ORDER(5, S); pg8::gemm_phase<EpiMergeH, ORDER_T(5, pg8::StaticOrder), true, true, MERGE_FP8 != 0>(lds, g, S2, E); } SEAM(5); }
        if (RUN(6)) { REP(6) { pg8::Gemm g{(const bf16*)(ws + WS_MSUM), (const bf16*)(ws + WS_WOUT), T, D, D / 2, D / 2, D / 2}; pg8::StaticOrder S; S.init(T, D, G, wg);
            EpiResid E{xin, (bf16*)(ws + WS_Y), 1.f / 64.f, l > 0};
            auto S2 = MAKE_ORDER(6, S); pg8::gemm_phase<EpiResid, ORDER_T(6, pg8::StaticOrder), true, true, true>(lds, g, S2, E); } SEAM(6); }
        if (RUN(7)) { REP(7) { phase_ln1_router(p, l, lds, wg, G, wave, lane, (PROBE_DUP == 7 && _r == 0) ? 16384 : 0); } SEAM(7); }
        if (RUN(8)) { REP(8) { const unsigned* cnt = (const unsigned*)(ws + WS_CTL) + CW_CNT + l * 4096; MoeTab M(lds); moe_tables(M, cnt, tid, lane, wave);
            UpOrder S{M, 0}; S.n = up_order_build(M, (const int*)(ws + WS_LIST), (const float*)(ws + WS_WL), wg, G, tid);
            constexpr int KU = MOE_UP_FP8 ? D / 2 : D;
            pg8::Gemm g{(const bf16*)(ws + WS_X1B), (const bf16*)(ws + WS_WUP), T, NEX * 1024, KU, KU, KU};
            EpiGluSparse E{(LAS const float*)M.wt, (bf16*)(ws + WS_HB)};
            auto S2 = MAKE_ORDER(8, S); pg8::gemm_phase_gather<EpiGluSparse, ORDER_T(8, UpOrder), MOE_UP_FP8 != 0>(lds, g, S2, E); } SEAM(8); }
        if (RUN(9)) { REP(9) { const unsigned* cnt = (const unsigned*)(ws + WS_CTL) + CW_CNT + l * 4096; MoeTab M(lds); moe_tables(M, cnt, tid, lane, wave);
            DownOrder S{M, G, wg, 8 * M.t[65]};
            constexpr int KD = MOE_DN_FP8 ? ED / 2 : ED;
            pg8::Gemm g{(const bf16*)(ws + WS_HB), (const bf16*)(ws + WS_WDN), HROWS, NEX * D, KD, KD, KD};
            EpiYexp E{(bf16*)(ws + WS_YEXP)};
            auto S2 = MAKE_ORDER(9, S); pg8::gemm_phase<EpiYexp, ORDER_T(9, DownOrder), true, true, MOE_DN_FP8 != 0>(lds, g, S2, E); } SEAM(9); }
        if (RUN(10)) { REP(10) { phase_combine_ln2(p, l, xout, l != NL - 1, gw, NGW, lane); } SEAM(10); }
#undef RUN
#undef SEAM
    }
}
__global__ void __launch_bounds__(512, 2) fwd_kernel(Params p) {
    extern __shared__ __attribute__((aligned(16))) unsigned char lds_raw[];
    LAS unsigned char* lds = (LAS unsigned char*)lds_raw;
    const int tid = threadIdx.x, lane = tid & 63, wave = __builtin_amdgcn_readfirstlane(tid >> 6);
    const int G = gridDim.x, wg = blockIdx.x, gw = wg * 8 + wave, NGW = G * 8;
    volatile LAS unsigned* MISC = (volatile LAS unsigned*)(lds + MISC_OFF);
    if (tid < 32) MISC[tid] = 0u;
    __syncthreads();
    unsigned* ctl = (unsigned*)(p.ws + WS_CTL);
    const bool multi = (p.ph_hi - p.ph_lo) > 1;
    XcdBarrier bar; bar.bar = ctl + CW_BAR; bar.x = 0; bar.st = nullptr;
    if (multi) bar = xcd_barrier_post(ctl + CW_BAR, MISC + 8);
    run_layer<0>(p, lds, bar, tid, lane, wave, G, wg, gw, NGW);
    run_layer<1>(p, lds, bar, tid, lane, wave, G, wg, gw, NGW);
}

#ifndef MK_MULTI_LAUNCH
#define MK_MULTI_LAUNCH 0
#endif
extern "C" void kernel_launch(void* const* d_in, const int* in_sizes, int n_in, void* d_out, int out_size, void* d_ws, size_t ws_size, hipStream_t stream) {
    static int grid = 0;
    if (grid == 0) {
        if (n_in != 27 || out_size != T * D || ws_size < WS_END) { fprintf(stderr, "kernel_launch: unexpected shapes (n_in %d out %d ws %zu need %zu)\n", n_in, out_size, ws_size, (size_t)WS_END); grid = -1; return; }
        int dev = 0, cus = 0, per_cu = 0;
        if (hipGetDevice(&dev) != hipSuccess || hipDeviceGetAttribute(&cus, hipDeviceAttributeMultiprocessorCount, dev) != hipSuccess) { grid = -1; return; }
        if (hipFuncSetAttribute((const void*)fwd_kernel, hipFuncAttributeMaxDynamicSharedMemorySize, LDS_BYTES) != hipSuccess) { fprintf(stderr, "kernel_launch: hipFuncSetAttribute failed\n"); grid = -1; return; }
        if (hipOccupancyMaxActiveBlocksPerMultiprocessor(&per_cu, (const void*)fwd_kernel, 512, LDS_BYTES) != hipSuccess || per_cu < 1) { fprintf(stderr, "kernel_launch: occupancy query says %d\n", per_cu); }
        (void)hipGetLastError();
        grid = cus;
    }
    if (grid < 0) return;
    (void)hipMemsetAsync((char*)d_ws + WS_CTL, 0, CTL_ZERO_BYTES, stream);
    Params p{};
    for (int i = 0; i < 27; ++i) p.in[i] = (const float*)d_in[i];
    p.out = (float*)d_out; p.ws = (unsigned char*)d_ws;
#if MK_MULTI_LAUNCH
    for (int ph = 0; ph < NL * NPH; ++ph) { p.ph_lo = ph; p.ph_hi = ph + 1; hipLaunchKernelGGL(fwd_kernel, dim3(grid), dim3(512), LDS_BYTES, stream, p); }
#else
    p.ph_lo = 0; p.ph_hi = NL * NPH; hipLaunchKernelGGL(fwd_kernel, dim3(grid), dim3(512), LDS_BYTES, stream, p);
#endif
}
```

```cpp
#include <hip/hip_runtime.h>
#include <cstdio>
#include <cstdint>
#include <type_traits>
namespace pg8 {
#define PG8_LAS __attribute__((address_space(3)))
typedef unsigned short bf16_t;
typedef short bf16x8 __attribute__((ext_vector_type(8)));
typedef float f32x4 __attribute__((ext_vector_type(4)));
typedef unsigned u32x4 __attribute__((ext_vector_type(4)));
constexpr int BM = 256, BK = 64, HALF = 128, HTB = HALF * BK * 2  , STAGE_BYTES = 8 * HTB, NXCD = 8, WGM = 8;

__host__ __device__ __forceinline__ int lds_byte(int r, int c) { const int st = (r >> 4) * 2 + (c >> 5), rr = r & 15, cc = c & 31, ob = rr * 64 + cc * 2; return st * 1024 + (ob ^ (((ob >> 9) & 1) << 5)); }
__host__ __device__ __forceinline__ void stage_rc(int b, int& R, int& C) { const int st = b / 1024, sb = b % 1024, swz = sb ^ (((sb >> 9) & 1) << 5); R = (st >> 1) * 16 + swz / 64; C = (st & 1) * 32 + (swz % 64) / 2; }
__host__ __device__ __forceinline__ int perm32(int rho) { const int n = rho >> 4, i = rho & 15; return 8 * (i >> 2) + 4 * n + (i & 3); }

struct Unit { int pm, pn, aux; };
struct Gemm { const bf16_t* A; const bf16_t* Bt; int M, N, K, lda, ldb; };

struct StaticOrder {
    int nM, nN, nwg, G, c;
    __host__ __device__ void init(int M, int N, int G_, int c_) { nM = M / BM; nN = N / BM; nwg = nM * nN; G = G_; c = c_; }
    __host__ __device__ bool next(int i, Unit& u) const {
        const long L = (long)i * G + c; if (L >= nwg) return false;
        int wgid = (int)L; { const int q = nwg / NXCD, r = nwg % NXCD, xcd = wgid % NXCD, off = wgid / NXCD; wgid = (xcd < r ? xcd * (q + 1) : r * (q + 1) + (xcd - r) * q) + off; }
        const int nig = WGM * nN, gid = wgid / nig, fm = gid * WGM, gsz = (nM - fm) < WGM ? (nM - fm) : WGM;
        u.pm = fm + ((wgid % nig) % gsz); u.pn = (wgid % nig) / gsz; return true;
    }
    __device__ __forceinline__ void a_ready(const Unit&) const {}
    __device__ __forceinline__ void done(const Unit&) const {}
};

__device__ __forceinline__ unsigned cvt_pk_bf16(float lo, float hi) { unsigned r; asm volatile("v_cvt_pk_bf16_f32 %0, %1, %2" : "=v"(r) : "v"(lo), "v"(hi)); return r; }
typedef float f32x2 __attribute__((ext_vector_type(2)));
__device__ __forceinline__ f32x2 gelu_pk(f32x2 v) {
    const f32x2 av = __builtin_elementwise_abs(v), d = av * 0.2316418882f + 1.0f;
    f32x2 t; t.x = __builtin_amdgcn_rcpf(d.x); t.y = __builtin_amdgcn_rcpf(d.y);
    f32x2 q = t * 0.5307027145f + (-0.7265760135f); q = q * t + 0.7107068705f; q = q * t + (-0.142248368f); q = q * t + 0.127414796f; q = q * t;
    const f32x2 s = (v * v) * (-0.72134752044f);
    f32x2 e; e.x = __builtin_amdgcn_exp2f(s.x); e.y = __builtin_amdgcn_exp2f(s.y);
    const f32x2 m = v * (q * e), r = v - m;
    f32x2 o; o.x = v.x < 0.f ? m.x : r.x; o.y = v.y < 0.f ? m.y : r.y; return o;
}

template <int ACT  > struct EpiBf16 {
    static constexpr bool PERM = true, AFTER_DRAIN = false; static constexpr int MID = 0; static_assert(ACT == 0 || ACT == 1, "EpiBf16: ACT is 0 (none) or 1 (gelu_pk)");
    bf16_t* O; int ldc; const float* bias; int split_cols; size_t split_stride; float scale0;
    __device__ __forceinline__ void operator()(const f32x4 (&acc)[2][2][4][2], const Unit& u, int wr, int wc, int fr, int fq) const {
        const int row0 = u.pm * BM + wr * 64 + fr; int colt = u.pn * BM; bf16_t* base = O;
        float sc = scale0; if (split_cols) { const int t = colt / split_cols; base += (size_t)t * split_stride; colt -= t * split_cols; if (t != 0) sc = 1.f; }
        const int col0 = colt + wc * 32 + 8 * fq, bcol0 = u.pn * BM + wc * 32 + 8 * fq;
        f32x4 bv[2][2];
#pragma unroll
        for (int bj = 0; bj < 2; ++bj)
#pragma unroll
            for (int n = 0; n < 2; ++n) bv[bj][n] = bias ? *(const f32x4*)(bias + bcol0 + bj * HALF + 4 * n) : (f32x4){0.f, 0.f, 0.f, 0.f};
#pragma unroll
        for (int ai = 0; ai < 2; ++ai)
#pragma unroll
            for (int m = 0; m < 4; ++m) { bf16_t* rowp = base + (size_t)(row0 + ai * HALF + m * 16) * ldc + col0;
#pragma unroll
                for (int bj = 0; bj < 2; ++bj) { f32x4 v0 = acc[ai][bj][m][0] + bv[bj][0], v1 = acc[ai][bj][m][1] + bv[bj][1];
                    if (ACT == 1) { f32x2 a = gelu_pk((f32x2){v0[0], v0[1]}), b = gelu_pk((f32x2){v0[2], v0[3]}), c = gelu_pk((f32x2){v1[0], v1[1]}), d = gelu_pk((f32x2){v1[2], v1[3]});
                        v0 = (f32x4){a.x, a.y, b.x, b.y}; v1 = (f32x4){c.x, c.y, d.x, d.y}; }
                    v0 = v0 * sc; v1 = v1 * sc; u32x4 w; w.x = cvt_pk_bf16(v0[0], v0[1]); w.y = cvt_pk_bf16(v0[2], v0[3]); w.z = cvt_pk_bf16(v1[0], v1[1]); w.w = cvt_pk_bf16(v1[2], v1[3]);
                    *(u32x4*)(rowp + bj * HALF) = w; } }
    }
};

typedef int i32x8 __attribute__((ext_vector_type(8)));
__device__ __forceinline__ i32x8 cat8(const bf16x8 a, const bf16x8 b) { typedef int i32x4 __attribute__((ext_vector_type(4))); const i32x4 x = __builtin_bit_cast(i32x4, a), y = __builtin_bit_cast(i32x4, b); return (i32x8){x[0], x[1], x[2], x[3], y[0], y[1], y[2], y[3]}; }
__device__ __forceinline__ bf16x8 lo8(const i32x8 v) { typedef int i32x4 __attribute__((ext_vector_type(4))); return __builtin_bit_cast(bf16x8, __builtin_shufflevector(v, v, 0, 1, 2, 3)); }
__device__ __forceinline__ bf16x8 hi8(const i32x8 v) { typedef int i32x4 __attribute__((ext_vector_type(4))); return __builtin_bit_cast(bf16x8, __builtin_shufflevector(v, v, 4, 5, 6, 7)); }
template <class Epi, class Sched, bool ALIGN_EPI = false, bool SP2 = false, bool FP8 = false>
__device__ __forceinline__ void gemm_phase(PG8_LAS unsigned char* lds, const Gemm g, const Sched& S, const Epi& E) {
    const int tid = threadIdx.x, wid = __builtin_amdgcn_readfirstlane(tid >> 6), lane = tid & 63, wr = wid >> 2, wc = wid & 3, fr = lane & 15, fq = lane >> 4;
    const int K = g.K, nt = K / BK;
    unsigned voffA[2], voffB[2];
#pragma unroll
    for (int i = 0; i < 2; ++i) { int R, C; stage_rc(tid * 16 + i * 8192, R, C); const int Rb = Epi::PERM ? ((R & ~31) + perm32(R & 31)) : R;
        voffA[i] = (unsigned)(R * g.lda + C) * 2u; voffB[i] = (unsigned)(Rb * g.ldb + C) * 2u; }
    const size_t kstep = (size_t)(BK * 2);
    const size_t hstepA = (size_t)HALF * g.lda * 2, hstepB = (size_t)HALF * g.ldb * 2;
    const size_t tstepA = 2 * hstepA, tstepB = 2 * hstepB;
    const unsigned ldsw = (unsigned)wid * 1024u;
    const int aoff = lds_byte(wr * 64 + fr, fq * 8), boff = lds_byte(wc * 32 + fr, fq * 8);
#define PG8_SA(b, h) (((b) * 2 + (h)) * HTB)
#define PG8_SB(b, h) ((4 + (b) * 2 + (h)) * HTB)
#define PG8_STAGE(bufoff, gbase, voff) do { _Pragma("unroll") for (int _i = 0; _i < 2; ++_i) \
        __builtin_amdgcn_global_load_lds((const unsigned*)((const char*)(gbase) + (voff)[_i]), (PG8_LAS unsigned*)(lds + (bufoff) + ldsw + _i * 8192), 16, 0, 0); } while (0)
#define PG8_LDA(dst, b, h) do { _Pragma("unroll") for (int m = 0; m < 4; ++m) { if constexpr (FP8) dst##8[m] = cat8(*(const PG8_LAS bf16x8*)(lds + PG8_SA(b, h) + aoff + m * 2048), *(const PG8_LAS bf16x8*)(lds + PG8_SA(b, h) + aoff + m * 2048 + 1024)); \
        else { _Pragma("unroll") for (int k = 0; k < 2; ++k) dst[m][k] = *(const PG8_LAS bf16x8*)(lds + PG8_SA(b, h) + aoff + m * 2048 + k * 1024); } } } while (0)
#define PG8_LDB(dst, b, h) do { _Pragma("unroll") for (int n = 0; n < 2; ++n) { if constexpr (FP8) dst##8[n] = cat8(*(const PG8_LAS bf16x8*)(lds + PG8_SB(b, h) + boff + n * 2048), *(const PG8_LAS bf16x8*)(lds + PG8_SB(b, h) + boff + n * 2048 + 1024)); \
        else { _Pragma("unroll") for (int k = 0; k < 2; ++k) dst[n][k] = *(const PG8_LAS bf16x8*)(lds + PG8_SB(b, h) + boff + n * 2048 + k * 1024); } } } while (0)
#define PG8_MMA(ai, bj, At, Bt) do { __builtin_amdgcn_s_setprio(1); _Pragma("unroll") for (int m = 0; m < 4; ++m) _Pragma("unroll") for (int n = 0; n < 2; ++n) { \
        if constexpr (FP8) asm volatile("v_mfma_scale_f32_16x16x128_f8f6f4 %0, %1, %2, %0, %3, %3 op_sel_hi:[0,0,0]" : "+v"(acc[ai][bj][m][n]) : "v"(Bt##8[n]), "v"(At##8[m]), "v"(fp8_unit_scale)); \
        else { _Pragma("unroll") for (int k = 0; k < 2; ++k) acc[ai][bj][m][n] = __builtin_amdgcn_mfma_f32_16x16x32_bf16(Bt[n][k], At[m][k], acc[ai][bj][m][n], 0, 0, 0); } } __builtin_amdgcn_s_setprio(0); } while (0)
#define PG8_WAIT_V(n) asm volatile("s_waitcnt vmcnt(" #n ")" ::: "memory")
#define PG8_WAIT_L(n) asm volatile("s_waitcnt lgkmcnt(" #n ")" ::: "memory")
#define PG8_BAR __builtin_amdgcn_s_barrier()
#define PG8_SCHED __builtin_amdgcn_sched_barrier(0)
    Unit cur, nxt; int ui = 0;
    if (!S.next(0, cur)) return;
    f32x4 acc[2][2][4][2];
#pragma unroll
    for (int a = 0; a < 2; ++a)
#pragma unroll
        for (int b = 0; b < 2; ++b)
#pragma unroll
            for (int m = 0; m < 4; ++m)
#pragma unroll
                for (int n = 0; n < 2; ++n) acc[a][b][m][n] = (f32x4){0.f, 0.f, 0.f, 0.f};
    int fp8_unit_scale = 0x7F7F7F7F; asm volatile("" : "+v"(fp8_unit_scale));
    bf16x8 At[4][2], B0[2][2], B1[2][2];
    i32x8 At8[4], B08[2], B18[2];
    const char* cA = (const char*)g.A + (size_t)cur.pm * tstepA; const char* cB = (const char*)g.Bt + (size_t)cur.pn * tstepB;
    S.a_ready(cur);
    if constexpr (SP2) {
        PG8_STAGE(PG8_SB(0, 0), cB, voffB); PG8_STAGE(PG8_SB(0, 1), cB + hstepB, voffB); PG8_STAGE(PG8_SA(0, 0), cA, voffA); PG8_STAGE(PG8_SA(0, 1), cA + hstepA, voffA);
        if (wr == 1) PG8_BAR;
        PG8_WAIT_V(2); PG8_BAR;
        PG8_STAGE(PG8_SB(1, 0), cB + kstep, voffB); PG8_STAGE(PG8_SA(1, 0), cA + kstep, voffA); PG8_STAGE(PG8_SB(1, 1), cB + hstepB + kstep, voffB);
        PG8_WAIT_V(6); PG8_BAR;
    } else {
        PG8_STAGE(PG8_SB(0, 0), cB, voffB); PG8_STAGE(PG8_SA(0, 0), cA, voffA); PG8_STAGE(PG8_SB(0, 1), cB + hstepB, voffB); PG8_STAGE(PG8_SA(0, 1), cA + hstepA, voffA);
        if (wr == 1) PG8_BAR;
        PG8_WAIT_V(4); PG8_BAR;
        PG8_STAGE(PG8_SB(1, 0), cB + kstep, voffB); PG8_STAGE(PG8_SA(1, 0), cA + kstep, voffA); PG8_STAGE(PG8_SB(1, 1), cB + hstepB + kstep, voffB);
        PG8_WAIT_V(6); PG8_BAR;
    }
    for (;;) {
        const bool has_next = S.next(ui + 1, nxt);
        const char* nA = has_next ? (const char*)g.A + (size_t)nxt.pm * tstepA : cA; const char* nB = has_next ? (const char*)g.Bt + (size_t)nxt.pn * tstepB : cB;
        for (int t = 0; t < nt; t += 2) {
            const bool last = (t == nt - 2);
            const char* a1 = cA + (size_t)(t + 1) * kstep;
            const char* a2 = last ? nA : cA + (size_t)(t + 2) * kstep; const char* b2 = last ? nB : cB + (size_t)(t + 2) * kstep;
            const char* a3 = a2 + kstep; const char* b3 = b2 + kstep;
            if (last && has_next) S.a_ready(nxt);
            if constexpr (SP2) {
            if constexpr (Epi::MID > 0) { if (t != 0 && (t % Epi::MID) == 0) { PG8_SCHED; if constexpr (FP8) asm volatile("s_nop 7\n\ts_nop 7" ::: "memory"); E.mid(acc, cur, t / Epi::MID, wr, wc, fr, fq); if constexpr (FP8) asm volatile("s_nop 7" ::: "memory"); PG8_SCHED; } }
            PG8_LDB(B0, 0, 0); PG8_LDB(B1, 0, 1); PG8_SCHED; PG8_LDA(At, 0, 0); PG8_STAGE(PG8_SA(1, 1), a1 + hstepA, voffA);
            PG8_WAIT_V(8); PG8_WAIT_L(0); PG8_BAR; PG8_MMA(0, 0, At, B0); PG8_MMA(0, 1, At, B1); PG8_BAR; PG8_SCHED;
            PG8_LDA(At, 0, 1); PG8_STAGE(PG8_SB(0, 0), b2, voffB); PG8_STAGE(PG8_SB(0, 1), b2 + hstepB, voffB); PG8_STAGE(PG8_SA(0, 0), a2, voffA);
            PG8_WAIT_V(8); PG8_WAIT_L(0); PG8_BAR; PG8_MMA(1, 0, At, B0); PG8_MMA(1, 1, At, B1); PG8_BAR; PG8_SCHED;
            PG8_LDB(B0, 1, 0); PG8_LDB(B1, 1, 1); PG8_SCHED; PG8_LDA(At, 1, 0); PG8_STAGE(PG8_SA(0, 1), a2 + hstepA, voffA);
            PG8_WAIT_V(8); PG8_WAIT_L(0); PG8_BAR; PG8_MMA(0, 0, At, B0); PG8_MMA(0, 1, At, B1); PG8_BAR; PG8_SCHED;
            PG8_LDA(At, 1, 1); PG8_STAGE(PG8_SB(1, 0), b3, voffB); PG8_STAGE(PG8_SB(1, 1), b3 + hstepB, voffB); PG8_STAGE(PG8_SA(1, 0), a3, voffA);
            PG8_WAIT_V(8); PG8_WAIT_L(0); PG8_BAR; PG8_MMA(1, 0, At, B0); PG8_MMA(1, 1, At, B1); PG8_BAR; PG8_SCHED;
            } else {
            PG8_LDB(B0, 0, 0); PG8_SCHED; PG8_LDA(At, 0, 0); PG8_STAGE(PG8_SA(1, 1), a1 + hstepA, voffA);
            PG8_WAIT_L(8); PG8_BAR; PG8_WAIT_L(0); PG8_MMA(0, 0, At, B0); PG8_BAR; PG8_SCHED;
            PG8_LDB(B1, 0, 1); PG8_STAGE(PG8_SB(0, 0), b2, voffB);
            PG8_BAR; PG8_WAIT_L(0); PG8_MMA(0, 1, At, B1); PG8_BAR;
            PG8_LDA(At, 0, 1); PG8_STAGE(PG8_SA(0, 0), a2, voffA);
            PG8_BAR; PG8_WAIT_L(0); PG8_MMA(1, 0, At, B0); PG8_BAR; PG8_SCHED;
            PG8_STAGE(PG8_SB(0, 1), b2 + hstepB, voffB);
            PG8_WAIT_V(6); PG8_BAR; PG8_MMA(1, 1, At, B1); PG8_BAR;
            PG8_LDB(B0, 1, 0); PG8_SCHED; PG8_LDA(At, 1, 0); PG8_STAGE(PG8_SA(0, 1), a2 + hstepA, voffA);
            PG8_WAIT_L(8); PG8_BAR; PG8_WAIT_L(0); PG8_MMA(0, 0, At, B0); PG8_BAR; PG8_SCHED;
            PG8_LDB(B1, 1, 1); PG8_STAGE(PG8_SB(1, 0), b3, voffB);
            PG8_BAR; PG8_WAIT_L(0); PG8_MMA(0, 1, At, B1); PG8_BAR;
            PG8_LDA(At, 1, 1); PG8_STAGE(PG8_SA(1, 0), a3, voffA);
            PG8_BAR; PG8_WAIT_L(0); PG8_MMA(1, 0, At, B0); PG8_BAR; PG8_SCHED;
            PG8_STAGE(PG8_SB(1, 1), b3 + hstepB, voffB);
            PG8_WAIT_V(6); PG8_BAR; PG8_MMA(1, 1, At, B1); PG8_BAR;
            }
        }
        if constexpr (ALIGN_EPI) { if (wr == 0) PG8_BAR; }
        if constexpr (FP8) asm volatile("s_nop 7\n\ts_nop 7" ::: "memory");
        if constexpr (!Epi::AFTER_DRAIN) { E(acc, cur, wr, wc, fr, fq); S.done(cur); }
        if (!has_next) break;
#pragma unroll
        for (int a = 0; a < 2; ++a)
#pragma unroll
            for (int b = 0; b < 2; ++b)
#pragma unroll
                for (int m = 0; m < 4; ++m)
#pragma unroll
                    for (int n = 0; n < 2; ++n) acc[a][b][m][n] = (f32x4){0.f, 0.f, 0.f, 0.f};
        cur = nxt; cA = nA; cB = nB; ++ui;
        if constexpr (ALIGN_EPI) { if (wr == 1) PG8_BAR; }
    }
    PG8_WAIT_V(0);
    if constexpr (!ALIGN_EPI) { if (wr == 0) PG8_BAR; }
    PG8_BAR;
    if constexpr (Epi::AFTER_DRAIN) { E.fused(acc, cur, wr, wc, fr, fq, lds, wid, lane); S.done(cur); }
#undef PG8_SA
#undef PG8_SB
#undef PG8_STAGE
#undef PG8_LDA
#undef PG8_LDB
#undef PG8_MMA
#undef PG8_WAIT_V
#undef PG8_WAIT_L
#undef PG8_BAR
#undef PG8_SCHED
}
template <class Epi, class Sched, bool FP8 = false>
__device__ __forceinline__ void gemm_phase_gather(PG8_LAS unsigned char* lds, const Gemm g, const Sched& S, const Epi& E) {
    const int tid = threadIdx.x, wid = __builtin_amdgcn_readfirstlane(tid >> 6), lane = tid & 63, wr = wid >> 2, wc = wid & 3, fr = lane & 15, fq = lane >> 4;
    const int K = g.K, nt = K / BK;
    unsigned voffB[2]; int RA[2], CA[2];
#pragma unroll
    for (int i = 0; i < 2; ++i) { int R, C; stage_rc(tid * 16 + i * 8192, R, C); const int Rb = Epi::PERM ? ((R & ~31) + perm32(R & 31)) : R;
        RA[i] = R; CA[i] = C; voffB[i] = (unsigned)(Rb * g.ldb + C) * 2u; }
    const size_t kstep = (size_t)(BK * 2);
    const size_t hstepB = (size_t)HALF * g.ldb * 2, tstepB = 2 * hstepB;
    const unsigned ldsw = (unsigned)wid * 1024u;
    const int aoff = lds_byte(wr * 64 + fr, fq * 8), boff = lds_byte(wc * 32 + fr, fq * 8);
#define PG8_SA(b, h) (((b) * 2 + (h)) * HTB)
#define PG8_SB(b, h) ((4 + (b) * 2 + (h)) * HTB)
#define PG8_STAGE(bufoff, gbase, voff) do { _Pragma("unroll") for (int _i = 0; _i < 2; ++_i) \
        __builtin_amdgcn_global_load_lds((const unsigned*)((const char*)(gbase) + (voff)[_i]), (PG8_LAS unsigned*)(lds + (bufoff) + ldsw + _i * 8192), 16, 0, 0); } while (0)
#define PG8_LDA(dst, b, h) do { _Pragma("unroll") for (int m = 0; m < 4; ++m) { if constexpr (FP8) dst##8[m] = cat8(*(const PG8_LAS bf16x8*)(lds + PG8_SA(b, h) + aoff + m * 2048), *(const PG8_LAS bf16x8*)(lds + PG8_SA(b, h) + aoff + m * 2048 + 1024)); \
        else { _Pragma("unroll") for (int k = 0; k < 2; ++k) dst[m][k] = *(const PG8_LAS bf16x8*)(lds + PG8_SA(b, h) + aoff + m * 2048 + k * 1024); } } } while (0)
#define PG8_LDB(dst, b, h) do { _Pragma("unroll") for (int n = 0; n < 2; ++n) { if constexpr (FP8) dst##8[n] = cat8(*(const PG8_LAS bf16x8*)(lds + PG8_SB(b, h) + boff + n * 2048), *(const PG8_LAS bf16x8*)(lds + PG8_SB(b, h) + boff + n * 2048 + 1024)); \
        else { _Pragma("unroll") for (int k = 0; k < 2; ++k) dst[n][k] = *(const PG8_LAS bf16x8*)(lds + PG8_SB(b, h) + boff + n * 2048 + k * 1024); } } } while (0)
#define PG8_MMA(ai, bj, At, Bt) do { __builtin_amdgcn_s_setprio(1); _Pragma("unroll") for (int m = 0; m < 4; ++m) _Pragma("unroll") for (int n = 0; n < 2; ++n) { \
        if constexpr (FP8) asm volatile("v_mfma_scale_f32_16x16x128_f8f6f4 %0, %1, %2, %0, %3, %3 op_sel_hi:[0,0,0]" : "+v"(acc[ai][bj][m][n]) : "v"(Bt##8[n]), "v"(At##8[m]), "v"(fp8_unit_scale)); \
        else { _Pragma("unroll") for (int k = 0; k < 2; ++k) acc[ai][bj][m][n] = __builtin_amdgcn_mfma_f32_16x16x32_bf16(Bt[n][k], At[m][k], acc[ai][bj][m][n], 0, 0, 0); } } __builtin_amdgcn_s_setprio(0); } while (0)
#define PG8_WAIT_V(n) asm volatile("s_waitcnt vmcnt(" #n ")" ::: "memory")
#define PG8_WAIT_L(n) asm volatile("s_waitcnt lgkmcnt(" #n ")" ::: "memory")
#define PG8_BAR __builtin_amdgcn_s_barrier()
#define PG8_SCHED __builtin_amdgcn_sched_barrier(0)
#define PG8_ROWS(dst, ui_) do { _Pragma("unroll") for (int _h = 0; _h < 2; ++_h) _Pragma("unroll") for (int _i = 0; _i < 2; ++_i) \
        dst[_h][_i] = (unsigned)S.row_token((ui_), _h * HALF + RA[_i]) * (unsigned)(g.lda * 2) + (unsigned)(CA[_i] * 2); } while (0)
    Unit cur, nxt; int ui = 0;
    if (!S.next(0, cur)) return;
    f32x4 acc[2][2][4][2];
#pragma unroll
    for (int a = 0; a < 2; ++a)
#pragma unroll
        for (int b = 0; b < 2; ++b)
#pragma unroll
            for (int m = 0; m < 4; ++m)
#pragma unroll
                for (int n = 0; n < 2; ++n) acc[a][b][m][n] = (f32x4){0.f, 0.f, 0.f, 0.f};
    int fp8_unit_scale = 0x7F7F7F7F; asm volatile("" : "+v"(fp8_unit_scale));
    bf16x8 At[4][2], B0[2][2], B1[2][2];
    i32x8 At8[4], B08[2], B18[2];
    unsigned offC[2][2];
    PG8_ROWS(offC, 0);
    const char* gA = (const char*)g.A;
    const char* cB = (const char*)g.Bt + (size_t)cur.pn * tstepB;
    PG8_STAGE(PG8_SB(0, 0), cB, voffB); PG8_STAGE(PG8_SB(0, 1), cB + hstepB, voffB); PG8_STAGE(PG8_SA(0, 0), gA, offC[0]); PG8_STAGE(PG8_SA(0, 1), gA, offC[1]);
    if (wr == 1) PG8_BAR;
    PG8_WAIT_V(2); PG8_BAR;
    PG8_STAGE(PG8_SB(1, 0), cB + kstep, voffB); PG8_STAGE(PG8_SA(1, 0), gA + kstep, offC[0]); PG8_STAGE(PG8_SB(1, 1), cB + hstepB + kstep, voffB);
    PG8_WAIT_V(6); PG8_BAR;
    for (;;) {
        const bool has_next = S.next(ui + 1, nxt);
        const char* nB = has_next ? (const char*)g.Bt + (size_t)nxt.pn * tstepB : cB;
        for (int t = 0; t < nt; t += 2) {
            const bool last = (t == nt - 2);
            const char* a1 = gA + (size_t)(t + 1) * kstep;
            const char* a2 = last ? gA : gA + (size_t)(t + 2) * kstep; const char* b2 = last ? nB : cB + (size_t)(t + 2) * kstep;
            const char* a3 = a2 + kstep; const char* b3 = b2 + kstep;
            PG8_LDB(B0, 0, 0); PG8_LDB(B1, 0, 1); PG8_SCHED; PG8_LDA(At, 0, 0); PG8_STAGE(PG8_SA(1, 1), a1, offC[1]);
            if (last && has_next) { PG8_ROWS(offC, ui + 1); }
            PG8_WAIT_V(8); PG8_WAIT_L(0); PG8_BAR; PG8_MMA(0, 0, At, B0); PG8_MMA(0, 1, At, B1); PG8_BAR; PG8_SCHED;
            PG8_LDA(At, 0, 1); PG8_STAGE(PG8_SB(0, 0), b2, voffB); PG8_STAGE(PG8_SB(0, 1), b2 + hstepB, voffB); PG8_STAGE(PG8_SA(0, 0), a2, offC[0]);
            PG8_WAIT_V(8); PG8_WAIT_L(0); PG8_BAR; PG8_MMA(1, 0, At, B0); PG8_MMA(1, 1, At, B1); PG8_BAR; PG8_SCHED;
            PG8_LDB(B0, 1, 0); PG8_LDB(B1, 1, 1); PG8_SCHED; PG8_LDA(At, 1, 0); PG8_STAGE(PG8_SA(0, 1), a2, offC[1]);
            PG8_WAIT_V(8); PG8_WAIT_L(0); PG8_BAR; PG8_MMA(0, 0, At, B0); PG8_MMA(0, 1, At, B1); PG8_BAR; PG8_SCHED;
            PG8_LDA(At, 1, 1); PG8_STAGE(PG8_SB(1, 0), b3, voffB); PG8_STAGE(PG8_SB(1, 1), b3 + hstepB, voffB); PG8_STAGE(PG8_SA(1, 0), a3, offC[0]);
            PG8_WAIT_V(8); PG8_WAIT_L(0); PG8_BAR; PG8_MMA(1, 0, At, B0); PG8_MMA(1, 1, At, B1); PG8_BAR; PG8_SCHED;
        }
        if (wr == 0) PG8_BAR;
        if constexpr (FP8) asm volatile("s_nop 7\n\ts_nop 7" ::: "memory");
        E(acc, cur, wr, wc, fr, fq); S.done(cur);
        if (!has_next) break;
#pragma unroll
        for (int a = 0; a < 2; ++a)
#pragma unroll
            for (int b = 0; b < 2; ++b)
#pragma unroll
                for (int m = 0; m < 4; ++m)
#pragma unroll
                    for (int n = 0; n < 2; ++n) acc[a][b][m][n] = (f32x4){0.f, 0.f, 0.f, 0.f};
        cur = nxt; cB = nB; ++ui;
        if (wr == 1) PG8_BAR;
    }
    PG8_WAIT_V(0);
    PG8_BAR;
#undef PG8_ROWS
#undef PG8_SA
#undef PG8_SB
#undef PG8_STAGE
#undef PG8_LDA
#undef PG8_LDB
#undef PG8_MMA
#undef PG8_WAIT_V
#undef PG8_WAIT_L
#undef PG8_BAR
#undef PG8_SCHED
}
}

#ifndef YEXP_FP8
#define YEXP_FP8 1
#endif
#ifndef CONV_SKIP
#define CONV_SKIP 6
#endif
#ifndef MERGE_FP8
#define MERGE_FP8 1
#endif
#ifndef MOE_DN_FP8
#define MOE_DN_FP8 1
#endif
#ifndef MOE_UP_FP8
#define MOE_UP_FP8 1
#endif
#ifndef PROBE_NOATOM
#define PROBE_NOATOM 0
#endif
constexpr int T = 8192, D = 2048, NL = 2, BW = 512, ZC = 14336, INC = 14352;
constexpr int NE = 64, NEX = 65  , ED = 512;
constexpr int BRW = 4 * BW;
constexpr int HK = NEX * ED;
constexpr float ALPHA = 1.41421356237f;
constexpr float LN_EPS = 1e-5f;
constexpr float UPSC = MOE_UP_FP8 ? (1.f / 64.f) : 1.f;
constexpr float BRSC = MERGE_FP8 ? 8.f : 1.f, MGSC = MERGE_FP8 ? (1.f / (8.f * 64.f)) : 1.f;
constexpr float YSC = 64.f;
constexpr float HSC = 8.f, DNSC = MOE_DN_FP8 ? (1.f / (HSC * 64.f)) : 1.f;
constexpr int ZC_SBQ = 0, ZC_SBK = 512, ZC_SBV = 1024, ZC_GMU = 1536, ZC_GMV = 2048, ZC_GDN = 2560, ZC_GDNG = 4096,
              ZC_MLQ = 4608, ZC_MLK = 4864, ZC_MLV = 5120, ZC_MLO = 5632, ZC_GATE = 6144;

#define GAS __attribute__((address_space(1)))
#define LAS __attribute__((address_space(3)))
typedef unsigned short bf16;
typedef unsigned v4u __attribute__((ext_vector_type(4)));
typedef unsigned v2u __attribute__((ext_vector_type(2)));
typedef float v4f __attribute__((ext_vector_type(4)));
typedef float v2f __attribute__((ext_vector_type(2)));
#define LDS_WAIT() asm volatile("s_waitcnt lgkmcnt(0)" ::: "memory")
#define LDS_BAR() do { asm volatile("s_waitcnt lgkmcnt(0)" ::: "memory"); __builtin_amdgcn_s_barrier(); asm volatile("" ::: "memory"); } while (0)

constexpr size_t MiB = 1u << 20;
constexpr size_t WS_CTL = 0, CTL_ZERO_BYTES = 1 * MiB;
constexpr size_t WS_WIN = 2 * MiB, WS_WBR = 58 * MiB, WS_WOUT = 66 * MiB, WS_WUP = 74 * MiB, WS_WDN = 334 * MiB;
constexpr size_t WS_XB = 464 * MiB, WS_SMALL = 496 * MiB, WS_EG = 497 * MiB, WS_BETA = WS_EG + 256 * 1024, WS_COMB = 498 * MiB;
constexpr size_t WS_Z = 500 * MiB, WS_GQ = 724 * MiB, WS_GK = 740 * MiB, WS_GV = 756 * MiB, WS_GO = 772 * MiB, WS_HO = 788 * MiB;
constexpr size_t WS_BR = 804 * MiB, WS_MTMP = 836 * MiB, WS_MSUM = 900 * MiB, WS_Y = 932 * MiB, WS_X1 = 996 * MiB, WS_X1B = 1060 * MiB;
constexpr size_t WS_XCUR = 1092 * MiB, WS_HB = 1156 * MiB, WS_YEXP = 1236 * MiB, WS_LIST = 1524 * MiB, WS_WL = 1526 * MiB, WS_SLOT = 1528 * MiB, WS_MQ = 1530 * MiB, WS_MS = 1534 * MiB, WS_MK = 1538 * MiB, WS_MV = 1542 * MiB, WS_MFL = 1552 * MiB, WS_HDEN = WS_MFL + 65536, WS_VT = 1553 * MiB, WS_END = 1561 * MiB;
constexpr size_t WS_GU = WS_GQ, WS_GNW = WS_GK, WS_GQG = WS_GK + 8 * MiB, WS_GKT = WS_GV, WS_GAT = WS_GV + 8 * MiB, WS_GDL = WS_GV + 12 * MiB;
constexpr int HROWS = 73728;
static_assert(WS_HB + (size_t)HROWS * ED * 2 <= WS_YEXP && WS_YEXP + (size_t)HROWS * D * 2 <= WS_LIST, "ws map (moe)");
static_assert(WS_WIN + (size_t)ZC * D * 2 <= WS_WBR && WS_WUP + (size_t)NEX * 1024 * D * 2 <= WS_WDN && WS_WDN + (size_t)D * HK * 2 <= WS_XB, "ws map (weights)");
static_assert(WS_Z + (size_t)T * ZC * 2 <= WS_GQ, "ws map (acts)");
constexpr int CW_BAR = 4096, CW_CNT = 16384;
constexpr int TAB_OFF = 131072 + 1024;
constexpr int LDS_BYTES = 163840, MISC_OFF = 131072 + 320;

__device__ __forceinline__ float bflo(unsigned w) { return __uint_as_float(w << 16); }
__device__ __forceinline__ float bfhi(unsigned w) { return __uint_as_float(w & 0xffff0000u); }
__device__ __forceinline__ unsigned f2bf(float f) { unsigned u = __float_as_uint(f); return (u + 0x7fffu + ((u >> 16) & 1u)) >> 16; }
typedef __bf16 bf16n2 __attribute__((ext_vector_type(2))); typedef float f32n2 __attribute__((ext_vector_type(2)));
__device__ __forceinline__ unsigned pk2(float lo, float hi) { const bf16n2 v = __builtin_convertvector((f32n2){lo, hi}, bf16n2); return __builtin_bit_cast(unsigned, v); }
__device__ __forceinline__ unsigned pk4_f8(float a, float b, float c, float d, float sc) {
    a = __builtin_amdgcn_fmed3f(a * sc, -448.f, 448.f); b = __builtin_amdgcn_fmed3f(b * sc, -448.f, 448.f); c = __builtin_amdgcn_fmed3f(c * sc, -448.f, 448.f); d = __builtin_amdgcn_fmed3f(d * sc, -448.f, 448.f);
    unsigned w = 0; w = __builtin_amdgcn_cvt_pk_fp8_f32(a, b, w, false); w = __builtin_amdgcn_cvt_pk_fp8_f32(c, d, w, true); return w; }
__device__ __forceinline__ v4f ld4(const void* base, size_t idx, bool is_bf16) {
    if (is_bf16) { const v2u r = *(const v2u*)((const unsigned short*)base + idx); return (v4f){bflo(r.x), bfhi(r.x), bflo(r.y), bfhi(r.y)}; }
    return *(const v4f*)((const float*)base + idx); }
template <int CTRL> __device__ __forceinline__ float dpp(float x) { return __builtin_bit_cast(float, __builtin_amdgcn_mov_dpp(__builtin_bit_cast(int, x), CTRL, 0xf, 0xf, true)); }
__device__ __forceinline__ float sum4(float x) { x += dpp<0xB1>(x); x += dpp<0x4E>(x); return x; }
__device__ __forceinline__ float sum8(float x) { x = sum4(x); x += dpp<0x141>(x); return x; }
__device__ __forceinline__ float sum16(float x) { x = sum8(x); x += dpp<0x140>(x); return x; }
__device__ __forceinline__ float wave_sum(float x) { x = sum16(x); x += __shfl_xor(x, 16); x += __shfl_xor(x, 32); return x; }
__device__ __forceinline__ float max8(float x) { x = fmaxf(x, dpp<0xB1>(x)); x = fmaxf(x, dpp<0x4E>(x)); x = fmaxf(x, dpp<0x141>(x)); return x; }
__device__ __forceinline__ float min8(float x) { x = fminf(x, dpp<0xB1>(x)); x = fminf(x, dpp<0x4E>(x)); x = fminf(x, dpp<0x141>(x)); return x; }
__device__ __forceinline__ float wave_scan_incl(float v) {
    v += __builtin_bit_cast(float, __builtin_amdgcn_update_dpp(0, __builtin_bit_cast(int, v), 0x111, 0xf, 0xf, true));
    v += __builtin_bit_cast(float, __builtin_amdgcn_update_dpp(0, __builtin_bit_cast(int, v), 0x112, 0xf, 0xf, true));
    v += __builtin_bit_cast(float, __builtin_amdgcn_update_dpp(0, __builtin_bit_cast(int, v), 0x114, 0xf, 0xf, true));
    v += __builtin_bit_cast(float, __builtin_amdgcn_update_dpp(0, __builtin_bit_cast(int, v), 0x118, 0xf, 0xf, true));
    v += __builtin_bit_cast(float, __builtin_amdgcn_update_dpp(0, __builtin_bit_cast(int, v), 0x142, 0xa, 0xf, false));
    v += __builtin_bit_cast(float, __builtin_amdgcn_update_dpp(0, __builtin_bit_cast(int, v), 0x143, 0xc, 0xf, false));
    return v;
}
__device__ __forceinline__ float sigmoidf_(float x) { return __builtin_amdgcn_rcpf(1.f + __expf(-x)); }
__device__ __forceinline__ float sigmoid_div(float x) { return 1.f / (1.f + __expf(-x)); }
__device__ __forceinline__ float siluf_(float x) { return x * __builtin_amdgcn_rcpf(1.f + __expf(-x)); }
__device__ __forceinline__ float softplusf_(float x) { return fmaxf(x, 0.f) + __logf(1.f + __expf(-fabsf(x))); }
__device__ __forceinline__ float gelu_tanh(float x) { const float y = 0.7978845608f * (x + 0.044715f * x * x * x); const float t = 1.f - 2.f * __builtin_amdgcn_rcpf(__expf(2.f * y) + 1.f); return 0.5f * x * (1.f + t); }
__device__ __forceinline__ void unpack8(const v4u r, float (&f)[8]) { f[0] = bflo(r.x); f[1] = bfhi(r.x); f[2] = bflo(r.y); f[3] = bfhi(r.y); f[4] = bflo(r.z); f[5] = bfhi(r.z); f[6] = bflo(r.w); f[7] = bfhi(r.w); }
#define XB_TMO      128
#define XB_XCNT(j)  (256  + 64 * (j))
#define XB_XSUB(j)  (1280 + 64 * (j))
#define XB_XGEN(j)  (2304 + 64 * (j))
#define XB_TOP      3328
#define XB_TOPGEN   3392
#define XCD_BAR_WORDS 3456
#define XB_SPIN_CAP (1u << 18)

__device__ __forceinline__ unsigned xb_ld(unsigned* p)              { return __hip_atomic_load(p, __ATOMIC_RELAXED, __HIP_MEMORY_SCOPE_AGENT); }
__device__ __forceinline__ unsigned xb_add(unsigned* p, unsigned v) { return __hip_atomic_fetch_add(p, v, __ATOMIC_RELAXED, __HIP_MEMORY_SCOPE_AGENT); }
__device__ __forceinline__ unsigned xb_xcc_id() { return (unsigned)__builtin_amdgcn_s_getreg((3 << 11) | 20) & 0xFu; }
#define XB_SPIN(cond, bar) do { unsigned _sp = 0; while (cond) { __builtin_amdgcn_s_sleep(1); \
    if ((++_sp & 255u) == 0u) { if (xb_ld(&(bar)[XB_TMO])) break; if (_sp > XB_SPIN_CAP) { atomicAdd(&(bar)[XB_TMO], 1u); break; } } } } while (0)

struct XcdBarrier {
    unsigned* bar; unsigned x;
    volatile LAS unsigned* st;
};

__device__ __forceinline__ XcdBarrier xcd_barrier_post(unsigned* bar, volatile LAS unsigned* st) {
    XcdBarrier b; b.bar = bar; b.x = xb_xcc_id(); b.st = st;
    if (threadIdx.x == 0) (void)xb_add(&bar[XB_XCNT(b.x)], 1u);
    return b;
}
__device__ __forceinline__ void xcd_barrier_complete(unsigned* bar, unsigned x, unsigned& nloc, unsigned& nx) {
    const unsigned G = gridDim.x * gridDim.y * gridDim.z;
    unsigned sum, cnt, mine, sp = 0u;
    for (;;) {
        sum = 0u; cnt = 0u; mine = 0u;
#pragma unroll
        for (unsigned j = 0; j < 16; ++j) { const unsigned c = xb_ld(&bar[XB_XCNT(j)]); sum += c; cnt += (c > 0u) ? 1u : 0u; mine = (j == x) ? c : mine; }
        if (sum == G) break;
        __builtin_amdgcn_s_sleep(1);
        if ((++sp & 255u) == 0u) { if (xb_ld(&bar[XB_TMO])) break; if (sp > XB_SPIN_CAP) { atomicAdd(&bar[XB_TMO], 1u); break; } }
    }
    nloc = mine > 0u ? mine : 1u; nx = cnt > 0u ? cnt : 1u;
}

__device__ __forceinline__ void xcd_barrier(const XcdBarrier& b) {
    asm volatile("s_waitcnt vmcnt(0)" ::: "memory");
    __syncthreads();
    if (threadIdx.x == 0) {
        unsigned* bar = b.bar;
        __builtin_amdgcn_s_waitcnt(0);
        unsigned nloc = b.st[0], nx = b.st[1];
        if (nloc == 0u) { xcd_barrier_complete(bar, b.x, nloc, nx); b.st[0] = nloc; b.st[1] = nx; }
        const unsigned old = xb_add(&bar[XB_XSUB(b.x)], 1u);
        const unsigned gen = old / nloc;
        if (old + 1u == (gen + 1u) * nloc) {
            __builtin_amdgcn_fence(__ATOMIC_RELEASE, "agent");
            asm volatile("s_waitcnt vmcnt(0)" ::: "memory");
            const unsigned og = xb_add(&bar[XB_TOP], 1u);
            const unsigned tg = og / nx;
            if (og + 1u == (tg + 1u) * nx) xb_add(&bar[XB_TOPGEN], 1u);
            else XB_SPIN(xb_ld(&bar[XB_TOPGEN]) == tg, bar);
            __builtin_amdgcn_fence(__ATOMIC_ACQUIRE, "agent");
            xb_add(&bar[XB_XGEN(b.x)], 1u);
            asm volatile("s_waitcnt vmcnt(0)" ::: "memory");
        } else {
            XB_SPIN(xb_ld(&bar[XB_XGEN(b.x)]) == gen, bar);
            __builtin_amdgcn_fence(__ATOMIC_ACQUIRE, "agent");
            asm volatile("s_waitcnt vmcnt(0)" ::: "memory");
        }
    }
    __syncthreads();
}

struct Params { const float* in[27]; float* out; unsigned char* ws; int ph_lo, ph_hi; };
enum { I_X = 0, I_WIN, I_GMNG, I_GMNB, I_GMWS, I_GMBS, I_CONVW, I_ALOG, I_DTB, I_GDNNG, I_MLIB, I_MLFB, I_MLNG, I_WBR, I_WOUT, I_LN1G, I_LN1B,
       I_WR, I_RB, I_WG, I_WU, I_WD, I_SG, I_SU, I_SD, I_LN2G, I_LN2B };

using pg8::f32x4; using pg8::u32x4; using pg8::Unit; using pg8::HALF; using pg8::BM;

struct EpiMergeH {
    static constexpr bool PERM = true, AFTER_DRAIN = false; static constexpr int MID = MERGE_FP8 ? BW / (2 * pg8::BK) : BW / pg8::BK;
    const bf16* Z; bf16* msum;
    __device__ __forceinline__ void mid(f32x4 (&acc)[2][2][4][2], const Unit& u, int j, int wr, int wc, int fr, int fq) const {
        int row0 = u.pm * BM + wr * 64 + fr; const int col0 = u.pn * BM + wc * 32 + 8 * fq; asm volatile("" : "+v"(row0));
        const bf16* zp = Z + ZC_GATE + (size_t)(j - 1) * D + col0;
        v4u ga[2][2][2], gb[2][2][2];
#define MH_LOAD(buf, am_) do { const int ai_ = (am_) >> 1, m0_ = ((am_) & 1) * 2; _Pragma("unroll") for (int m = 0; m < 2; ++m) _Pragma("unroll") for (int bj = 0; bj < 2; ++bj) { \
            const bf16* q = zp + (size_t)(row0 + ai_ * HALF + (m0_ + m) * 16) * ZC + bj * HALF; ga[buf][m][bj] = *(const v4u*)q; gb[buf][m][bj] = *(const v4u*)(q + D); } } while (0)
#define MH_APPLY(buf, am_) do { const int ai_ = (am_) >> 1, m0_ = ((am_) & 1) * 2; _Pragma("unroll") for (int m = 0; m < 2; ++m) _Pragma("unroll") for (int bj = 0; bj < 2; ++bj) { float a[8], b[8]; unpack8(ga[buf][m][bj], a); unpack8(gb[buf][m][bj], b); \
            _Pragma("unroll") for (int i = 0; i < 8; ++i) { const float ea = __builtin_amdgcn_exp2f(fmaxf(a[i], -60.f) * -1.44269504f), eb = __builtin_amdgcn_exp2f(fmaxf(b[i], -60.f) * -1.44269504f); \
                acc[ai_][bj][m0_ + m][i >> 2][i & 3] *= (1.f + eb) * __builtin_amdgcn_rcpf(1.f + ea); } } } while (0)
        MH_LOAD(0, 0); MH_LOAD(1, 1); asm volatile("" ::: "memory");
        MH_APPLY(0, 0); asm volatile("" ::: "memory"); MH_LOAD(0, 2); asm volatile("" ::: "memory");
        MH_APPLY(1, 1); asm volatile("" ::: "memory"); MH_LOAD(1, 3); asm volatile("" ::: "memory");
        MH_APPLY(0, 2); asm volatile("" ::: "memory");
        MH_APPLY(1, 3); asm volatile("" ::: "memory");
#undef MH_LOAD
#undef MH_APPLY
    }
    __device__ __forceinline__ void operator()(const f32x4 (&acc)[2][2][4][2], const Unit& u, int wr, int wc, int fr, int fq) const {
        const int row0 = u.pm * BM + wr * 64 + fr, col0 = u.pn * BM + wc * 32 + 8 * fq;
#pragma unroll
        for (int ai = 0; ai < 2; ++ai) { v4u gg[4][2];
#pragma unroll
            for (int m = 0; m < 4; ++m)
#pragma unroll
                for (int bj = 0; bj < 2; ++bj) gg[m][bj] = *(const v4u*)(Z + (size_t)(row0 + ai * HALF + m * 16) * ZC + ZC_GATE + 3 * D + col0 + bj * HALF);
#pragma unroll
            for (int m = 0; m < 4; ++m)
#pragma unroll
                for (int bj = 0; bj < 2; ++bj) { const size_t row = (size_t)(row0 + ai * HALF + m * 16); const int col = col0 + bj * HALF; float gl[8]; unpack8(gg[m][bj], gl);
                    f32x4 v0 = acc[ai][bj][m][0], v1 = acc[ai][bj][m][1];
#pragma unroll
                    for (int j = 0; j < 4; ++j) { v0[j] *= sigmoidf_(gl[j]) * MGSC; v1[j] *= sigmoidf_(gl[4 + j]) * MGSC; }
                    unsigned w0 = 0, w1 = 0; w0 = __builtin_amdgcn_cvt_pk_fp8_f32(v0[0], v0[1], w0, false); w0 = __builtin_amdgcn_cvt_pk_fp8_f32(v0[2], v0[3], w0, true); w1 = __builtin_amdgcn_cvt_pk_fp8_f32(v1[0], v1[1], w1, false); w1 = __builtin_amdgcn_cvt_pk_fp8_f32(v1[2], v1[3], w1, true);
                    *(v2u*)((unsigned char*)msum + row * D + col) = (v2u){w0, w1}; }
            asm volatile("" ::: "memory"); }
    }
};
struct EpiResid {
    static constexpr bool PERM = true, AFTER_DRAIN = false; static constexpr int MID = 0;
    const void* X; bf16* Y; float sc; bool xbf;
    __device__ __forceinline__ void operator()(const f32x4 (&acc)[2][2][4][2], const Unit& u, int wr, int wc, int fr, int fq) const {
        const int row0 = u.pm * BM + wr * 64 + fr, col0 = u.pn * BM + wc * 32 + 8 * fq;
#pragma unroll
        for (int ai = 0; ai < 2; ++ai)
#pragma unroll
            for (int m = 0; m < 4; ++m) { const size_t off = (size_t)(row0 + ai * HALF + m * 16) * D + col0;
#pragma unroll
                for (int bj = 0; bj < 2; ++bj) { const f32x4 x0 = ld4(X, off + bj * HALF, xbf), x1 = ld4(X, off + bj * HALF + 4, xbf);
                    const f32x4 v0 = x0 * ALPHA + acc[ai][bj][m][0] * sc, v1 = x1 * ALPHA + acc[ai][bj][m][1] * sc;
                    u32x4 w; w.x = pk2(v0[0], v0[1]); w.y = pk2(v0[2], v0[3]); w.z = pk2(v1[0], v1[1]); w.w = pk2(v1[2], v1[3]); *(u32x4*)(Y + off + bj * HALF) = w; } }
    }
};
struct MoeTab {
    LAS int* t; LAS unsigned short* tok; LAS float* wt; LAS unsigned char* mte;
    __device__ __forceinline__ MoeTab(LAS unsigned char* lds) : t((LAS int*)(lds + TAB_OFF)), tok((LAS unsigned short*)(lds + TAB_OFF + 1024)), wt((LAS float*)(lds + TAB_OFF + 5120)), mte((LAS unsigned char*)(lds + TAB_OFF + 13312)) {}
};
__device__ __forceinline__ void moe_tables(const MoeTab& M, const unsigned* cnt  , int tid, int lane, int wave) {
    __syncthreads();
    if (wave == 0) { const int c = (int)cnt[64 * lane]; const int tiles = (c + 255) >> 8; const float incl = wave_scan_incl((float)tiles);
        M.t[80 + lane] = c; M.t[lane] = (int)incl - tiles; if (lane == 63) { M.t[64] = (int)incl; M.t[65] = (int)incl + T / 256; M.t[80 + 64] = T; } }
    __syncthreads();
    const int Mt = M.t[65];
    for (int mt = tid; mt < Mt; mt += 512) { int e = 0;
        for (int k = 1; k <= 64; ++k) e = (M.t[k] <= mt) ? k : e;
        M.mte[mt] = (unsigned char)e; }
    __syncthreads();
}
struct UpOrder {
    MoeTab M; int n;
    __device__ __forceinline__ bool next(int i, Unit& u) const { if (i >= n) return false; u.pm = M.t[168 + i]; u.pn = M.t[176 + i]; u.aux = i; return true; }
    __device__ __forceinline__ int row_token(int i, int r) const { return (int)M.tok[i * 256 + r]; }
    __device__ __forceinline__ void a_ready(const Unit&) const {}
    __device__ __forceinline__ void done(const Unit&) const {}
};
__device__ __forceinline__ int up_order_build(const MoeTab& M, const int* LIST, const float* WL, int wg, int G, int tid) {
    const int U = 4 * M.t[65];
    if (tid < 8) { const int L = tid * G + wg; if (L < U) { const int mt = L >> 2, q = L & 3, e = M.mte[mt]; M.t[168 + tid] = mt; M.t[176 + tid] = e * 4 + q; M.t[184 + tid] = e; M.t[192 + tid] = mt - M.t[e]; } }
    int n = 0;
#pragma unroll
    for (int i = 0; i < 8; ++i) n += (i * G + wg < U) ? 1 : 0;
    __syncthreads();
    for (int idx = tid; idx < n * 256; idx += 512) { const int i = idx >> 8, r = idx & 255, e = M.t[184 + i], li = M.t[192 + i] * 256 + r;
        int tk = 0; float w = 0.f;
        if (e < NE) { if (li < M.t[80 + e]) { tk = LIST[e * T + li]; w = WL[e * T + li]; } } else { tk = li; w = 1.f; }
        M.tok[idx] = (unsigned short)tk; M.wt[idx] = w; }
    __syncthreads();
    return n;
}
struct EpiGluSparse {
    static constexpr bool PERM = true, AFTER_DRAIN = false; static constexpr int MID = 0;
    LAS const float* wt; bf16* H;
    __device__ __forceinline__ void operator()(const f32x4 (&acc)[2][2][4][2], const Unit& u, int wr, int wc, int fr, int fq) const {
        const int q = u.pn & 3; const int rl0 = wr * 64 + fr, col0 = q * 128 + wc * 32 + 8 * fq;
#pragma unroll
        for (int ai = 0; ai < 2; ++ai)
#pragma unroll
            for (int m = 0; m < 4; ++m) { const int rl = rl0 + ai * HALF + m * 16; const float c = wt[u.aux * 256 + rl]; float h[8];
#pragma unroll
                for (int n = 0; n < 2; ++n)
#pragma unroll
                    for (int j = 0; j < 4; ++j) h[4 * n + j] = siluf_(acc[ai][0][m][n][j] * UPSC) * (acc[ai][1][m][n][j] * UPSC) * c;
#if MOE_DN_FP8
#pragma unroll
                for (int j = 0; j < 8; ++j) h[j] = __builtin_amdgcn_fmed3f(h[j] * HSC, -448.f, 448.f);
                unsigned w0 = 0, w1 = 0; w0 = __builtin_amdgcn_cvt_pk_fp8_f32(h[0], h[1], w0, false); w0 = __builtin_amdgcn_cvt_pk_fp8_f32(h[2], h[3], w0, true); w1 = __builtin_amdgcn_cvt_pk_fp8_f32(h[4], h[5], w1, false); w1 = __builtin_amdgcn_cvt_pk_fp8_f32(h[6], h[7], w1, true);
                *(v2u*)((unsigned char*)H + ((size_t)u.pm * 256 + rl) * ED + col0) = (v2u){w0, w1}; }
#else
                u32x4 w; w.x = pk2(h[0], h[1]); w.y = pk2(h[2], h[3]); w.z = pk2(h[4], h[5]); w.w = pk2(h[6], h[7]);
                *(u32x4*)(H + ((size_t)u.pm * 256 + rl) * ED + col0) = w; }
#endif
    }
};
struct DownOrder {
    MoeTab M; int G, c, U;
    __device__ __forceinline__ bool next(int i, Unit& u) const { const int L = i * G + c; if (L >= U) return false; const int mt = L >> 3, e = (int)M.mte[mt]; u.pm = mt; u.pn = e * 8 + (L & 7); const int left = M.t[80 + e] - 256 * (mt - M.t[e]); u.aux = left < 256 ? left : 256; return true; }
    __device__ __forceinline__ void a_ready(const Unit&) const {}
    __device__ __forceinline__ void done(const Unit&) const {}
};
struct EpiYexp {
    static constexpr bool PERM = true, AFTER_DRAIN = false; static constexpr int MID = 0;
    bf16* Y;
    __device__ __forceinline__ void operator()(const f32x4 (&acc)[2][2][4][2], const Unit& u, int wr, int wc, int fr, int fq) const {
        const int row0 = u.pm * BM + wr * 64 + fr, col0 = (u.pn & 7) * BM + wc * 32 + 8 * fq;
#pragma unroll
        for (int ai = 0; ai < 2; ++ai)
#pragma unroll
            for (int m = 0; m < 4; ++m) { bf16* rowp = Y + (size_t)(row0 + ai * HALF + m * 16) * D + col0;
                if (wr * 64 + fr + ai * HALF + m * 16 >= u.aux) continue;
#pragma unroll
                for (int bj = 0; bj < 2; ++bj) { const f32x4 v0 = acc[ai][bj][m][0] * DNSC, v1 = acc[ai][bj][m][1] * DNSC;
#if YEXP_FP8
                    *(v2u*)((unsigned char*)Y + (size_t)(row0 + ai * HALF + m * 16) * D + col0 + bj * HALF) = (v2u){pk4_f8(v0[0], v0[1], v0[2], v0[3], YSC), pk4_f8(v1[0], v1[1], v1[2], v1[3], YSC)}; } }
#else
                    u32x4 w; w.x = pk2(v0[0], v0[1]); w.y = pk2(v0[2], v0[3]); w.z = pk2(v1[0], v1[1]); w.w = pk2(v1[2], v1[3]); *(u32x4*)(rowp + bj * HALF) = w; } }
#endif
    }
};

struct TrItem { const float* src; bf16* dst; unsigned sld, dld; int f8; };
__device__ __forceinline__ void tr_load(const TrItem& t, int lane, v4f (&v)[8]) { const int r8 = lane >> 3, c4 = lane & 7;
#pragma unroll
    for (int i = 0; i < 8; ++i) v[i] = *(const v4f*)(t.src + (size_t)(8 * i + r8) * t.sld + 4 * c4); }
__device__ __forceinline__ void tr_store(const TrItem& t, const v4f (&v)[8], LAS float* scr, int lane, bool nostore = false) {
    { const int r8 = lane >> 3, c4 = lane & 7;
#pragma unroll
      for (int i = 0; i < 8; ++i) { LAS float* d = scr + (8 * i + r8) * 33 + 4 * c4; d[0] = v[i].x; d[1] = v[i].y; d[2] = v[i].z; d[3] = v[i].w; } }
    LDS_WAIT(); asm volatile("" ::: "memory");
    if (nostore) return;
    if (t.f8) {
        const int c = lane & 3;
#pragma unroll
        for (int j = 0; j < 2; ++j) { const int n = (lane >> 2) + 16 * j; const LAS float* s = scr + (16 * c) * 33 + n; unsigned w[4];
#pragma unroll
            for (int q = 0; q < 4; ++q) { unsigned x = 0; x = __builtin_amdgcn_cvt_pk_fp8_f32(s[(4 * q) * 33] * 64.f, s[(4 * q + 1) * 33] * 64.f, x, false); x = __builtin_amdgcn_cvt_pk_fp8_f32(s[(4 * q + 2) * 33] * 64.f, s[(4 * q + 3) * 33] * 64.f, x, true); w[q] = x; }
            *(v4u*)((unsigned char*)t.dst + (size_t)n * t.dld + 16 * c) = (v4u){w[0], w[1], w[2], w[3]}; }
    } else {
        const int c = lane & 7;
#pragma unroll
        for (int j = 0; j < 4; ++j) { const int n = (lane >> 3) + 8 * j; const LAS float* s = scr + (8 * c) * 33 + n;
            v4u o; o.x = pk2(s[0 * 33], s[1 * 33]); o.y = pk2(s[2 * 33], s[3 * 33]); o.z = pk2(s[4 * 33], s[5 * 33]); o.w = pk2(s[6 * 33], s[7 * 33]);
            *(v4u*)(t.dst + (size_t)n * t.dld + 8 * c) = o; }
    }
    LDS_WAIT(); asm volatile("" ::: "memory");
}
template <int PART> __device__ __forceinline__ TrItem tr_decode(const Params& p, int l, int it) {
    unsigned char* ws = p.ws;
    constexpr int N_IN = (ZC / 32) * (D / 64), N_BR = 4 * (BW / 64) * (D / 32), N_OUT = (D / 64) * (D / 32), N_UP = NEX * 2 * (D / 64) * (ED / 32);
    int r = it; TrItem t; t.f8 = 0;
    if (PART == 0) {
        const float* w_in = p.in[I_WIN] + (size_t)l * D * INC; const float* w_br = p.in[I_WBR] + (size_t)l * 4 * BW * D; const float* w_out = p.in[I_WOUT] + (size_t)l * D * D;
        bf16* WIN = (bf16*)(ws + WS_WIN); bf16* WBR = (bf16*)(ws + WS_WBR); bf16* WOUT = (bf16*)(ws + WS_WOUT);
        if (r < N_IN) { const int kb = r / (ZC / 32), n0 = (r % (ZC / 32)) * 32, k0 = kb * 64; const int sc = n0 + (n0 >= ZC_GATE ? 16 : (n0 >= ZC_MLQ ? 8 : 0));
            t.src = w_in + (size_t)k0 * INC + sc; t.sld = INC; t.dst = (bf16*)((unsigned char*)WIN + (size_t)n0 * D + k0); t.dld = D; t.f8 = 1; return t; } r -= N_IN;
        if (r < N_BR) { const int g = r / 512, rr = r % 512, k0 = (rr / 64) * 64, n0 = (rr % 64) * 32;
            t.src = w_br + ((size_t)g * BW + k0) * D + n0; t.sld = D;
#if MERGE_FP8
            t.dst = (bf16*)((unsigned char*)WBR + (size_t)n0 * BRW + g * BW + k0); t.dld = BRW; t.f8 = 1; return t; }
#else
            t.dst = WBR + (size_t)n0 * BRW + g * BW + k0; t.dld = BRW; return t; }
#endif
        r -= N_BR;
        { const int k0 = (r / 64) * 64, n0 = (r % 64) * 32; t.src = w_out + (size_t)k0 * D + n0; t.sld = D; t.dst = (bf16*)((unsigned char*)WOUT + (size_t)n0 * D + k0); t.dld = D; t.f8 = 1; return t; }
    } else {
        const float* w_g = p.in[I_WG] + (size_t)l * NE * D * ED; const float* w_u = p.in[I_WU] + (size_t)l * NE * D * ED; const float* w_d = p.in[I_WD] + (size_t)l * NE * ED * D;
        const float* s_g = p.in[I_SG] + (size_t)l * D * ED; const float* s_u = p.in[I_SU] + (size_t)l * D * ED; const float* s_d = p.in[I_SD] + (size_t)l * ED * D;
        bf16* WUP = (bf16*)(ws + WS_WUP); bf16* WDN = (bf16*)(ws + WS_WDN);
        if (r < N_UP) { const int e = r / 1024, rr = r % 1024, mat = rr / 512, r2 = rr % 512, k0 = (r2 / 16) * 64, n0 = (r2 % 16) * 32;
            const float* sb = (e < NE) ? ((mat ? w_u : w_g) + (size_t)e * D * ED) : (mat ? s_u : s_g);
            const int drow = e * 1024 + (n0 / 128) * 256 + mat * 128 + (n0 % 128);
            t.src = sb + (size_t)k0 * ED + n0; t.sld = ED;
#if MOE_UP_FP8
            t.dst = (bf16*)((unsigned char*)WUP + (size_t)drow * D + k0); t.dld = D; t.f8 = 1; return t; }
#else
            t.dst = WUP + (size_t)drow * D + k0; t.dld = D; return t; }
#endif
        r -= N_UP;
        { const int e = r / 512, rr = r % 512, k0 = (rr / 64) * 64, n0 = (rr % 64) * 32;
            const float* sb = (e < NE) ? (w_d + (size_t)e * ED * D) : s_d;
            t.src = sb + (size_t)k0 * D + n0; t.sld = D;
#if MOE_DN_FP8
            t.dst = (bf16*)((unsigned char*)WDN + ((size_t)e * D + n0) * ED + k0); t.dld = ED; t.f8 = 1; return t; }
#else
            t.dst = WDN + ((size_t)e * D + n0) * ED + k0; t.dld = ED; return t; }
#endif
    }
}
template <int PART> __device__ __forceinline__ void phase_convert(const Params& p, int l, LAS unsigned char* lds, int gw, int NGW, int wave, int lane, bool nostore = false, int lo = 0, int hi = 1 << 30) {
    constexpr int N_IN = (ZC / 32) * (D / 64), N_BR = 4 * (BW / 64) * (D / 32), N_OUT = (D / 64) * (D / 32), N_UP = NEX * 2 * (D / 64) * (ED / 32), N_DN = NEX * (ED / 64) * (D / 32);
    constexpr int NITEMS = (PART == 0) ? (N_IN + N_BR + N_OUT) : (N_UP + N_DN);
    LAS float* scr = (LAS float*)(lds + wave * 16384);
    const int NIT = hi < NITEMS ? hi : NITEMS;
    if (lo + gw >= NIT) return;
    TrItem cur = tr_decode<PART>(p, l, lo + gw); v4f va[8], vb[8];
    tr_load(cur, lane, va);
    for (int it = lo + gw; it < NIT; it += 2 * NGW) {
        const int i1 = it + NGW, i2 = it + 2 * NGW; TrItem nx = cur;
        if (i1 < NIT) { nx = tr_decode<PART>(p, l, i1); } tr_load(nx, lane, vb);
        tr_store(cur, va, scr, lane, nostore);
        if (i1 >= NIT) break;
        cur = nx; if (i2 < NIT) { cur = tr_decode<PART>(p, l, i2); } tr_load(cur, lane, va);
        tr_store(nx, vb, scr, lane, nostore);
        if (i2 >= NIT) break;
    }
}
__device__ __forceinline__ void phase_xprep(const Params& p, int l, const void* xin, bool xbf, LAS unsigned char* lds, int gw, int NGW, int tid, int lane) {
    const float* w_in = p.in[I_WIN] + (size_t)l * D * INC;
    constexpr int XP = 2052; LAS float* xt = (LAS float*)lds; LAS float* part = (LAS float*)lds;
    const int wave = tid >> 6, n_l = lane & 15, kq = lane >> 4, wg = gw >> 3, G = NGW >> 3;
    const int colw = n_l < 8 ? 4608 + n_l : 6152 + (n_l - 8);
    float bw[64];
#pragma unroll
    for (int q = 0; q < 64; ++q) bw[q] = w_in[(size_t)(256 * wave + 16 * (q >> 2) + 4 * kq + (q & 3)) * INC + colw];
    unsigned char* XB = p.ws + WS_XB; float* SMALL = (float*)(p.ws + WS_SMALL);
    __syncthreads();
    for (int tg = wg; tg < T / 16; tg += G) {
        {   v4f va[8], vb[8]; const size_t m0 = (size_t)tg * 16 + 2 * wave;
#pragma unroll
            for (int j = 0; j < 8; ++j) { va[j] = ld4(xin, m0 * D + 4 * lane + 256 * j, xbf); vb[j] = ld4(xin, (m0 + 1) * D + 4 * lane + 256 * j, xbf); }
#pragma unroll
            for (int rr = 0; rr < 2; ++rr) { unsigned* xo = (unsigned*)(XB + (m0 + rr) * D) + lane;
#pragma unroll
                for (int j = 0; j < 8; ++j) { const v4f v = rr ? vb[j] : va[j]; unsigned w = 0; w = __builtin_amdgcn_cvt_pk_fp8_f32(v.x, v.y, w, false); w = __builtin_amdgcn_cvt_pk_fp8_f32(v.z, v.w, w, true); xo[64 * j] = w;
                    *(LAS v4f*)(xt + (2 * wave + rr) * XP + 4 * lane + 256 * j) = v; } } }
        __syncthreads();
        {   pg8::f32x4 acc[4];
#pragma unroll
            for (int i = 0; i < 4; ++i) acc[i] = (pg8::f32x4){0.f, 0.f, 0.f, 0.f};
            const LAS float* xa = xt + n_l * XP + 256 * wave + 4 * kq;
#pragma unroll
            for (int s2 = 0; s2 < 16; ++s2) { const v4f a4 = *(const LAS v4f*)(xa + 16 * s2);
                acc[0] = __builtin_amdgcn_mfma_f32_16x16x4f32(a4.x, bw[4 * s2 + 0], acc[0], 0, 0, 0); acc[1] = __builtin_amdgcn_mfma_f32_16x16x4f32(a4.y, bw[4 * s2 + 1], acc[1], 0, 0, 0);
                acc[2] = __builtin_amdgcn_mfma_f32_16x16x4f32(a4.z, bw[4 * s2 + 2], acc[2], 0, 0, 0); acc[3] = __builtin_amdgcn_mfma_f32_16x16x4f32(a4.w, bw[4 * s2 + 3], acc[3], 0, 0, 0); }
            const pg8::f32x4 tot = (acc[0] + acc[1]) + (acc[2] + acc[3]);
            __syncthreads();
#pragma unroll
            for (int j = 0; j < 4; ++j) part[(wave * 16 + 4 * kq + j) * 16 + n_l] = tot[j]; }
        __syncthreads();
        if (tid < 256) { float a = 0.f;
#pragma unroll
            for (int w = 0; w < 8; ++w) a += part[w * 256 + tid];
            SMALL[(size_t)tg * 256 + tid] = a; }
        __syncthreads();
    }
}


typedef short bf16x8_t __attribute__((ext_vector_type(8)));
__device__ __forceinline__ void ml_pre_item(const Params& p, int l, LAS unsigned char* lds, int item, int tid, int wave, int lane) {
    const int h = item & 3, n = item >> 2; const size_t t0 = (size_t)n * 64;
    const bf16* Z = (const bf16*)(p.ws + WS_Z); const float* SMALL = (const float*)(p.ws + WS_SMALL);
    bf16* MQ = (bf16*)(p.ws + WS_MQ) + (size_t)item * 4096; bf16* MS = (bf16*)(p.ws + WS_MS) + (size_t)item * 4096; bf16* MK = (bf16*)(p.ws + WS_MK) + (size_t)item * 4096;
    bf16* MV = (bf16*)(p.ws + WS_MV) + (size_t)item * 9216; float* MFL = (float*)(p.ws + WS_MFL);
    LAS float* qs = (LAS float*)lds;
    LAS float* ks = qs + 64 * 65;
    LAS float* bs = ks + 64 * 65;
    LAS unsigned short* vs = (LAS unsigned short*)(bs + 128);
    { const int tk = tid >> 3, c8 = tid & 7; float f[8];
      unpack8(*(const v4u*)(Z + (t0 + tk) * ZC + ZC_MLQ + h * 64 + 8 * c8), f);
#pragma unroll
      for (int i = 0; i < 8; ++i) qs[tk * 65 + 8 * c8 + i] = f[i];
      unpack8(*(const v4u*)(Z + (t0 + tk) * ZC + ZC_MLK + h * 64 + 8 * c8), f);
#pragma unroll
      for (int i = 0; i < 8; ++i) ks[tk * 65 + 8 * c8 + i] = f[i]; }
#pragma unroll
    for (int r = 0; r < 2; ++r) { const int idx = tid + 512 * r, tk = idx >> 4, c8 = idx & 15;
        *(LAS v4u*)(vs + tk * 136 + 8 * c8) = *(const v4u*)(Z + (t0 + tk) * ZC + ZC_MLV + h * 128 + 8 * c8); }
    if (wave == 0) { const float fp = SMALL[(t0 + lane) * 16 + 12 + h] + p.in[I_MLFB][l * 4 + h]; const float lf = -softplusf_(-fp);
        bs[lane] = wave_scan_incl(lf); bs[64 + lane] = SMALL[(t0 + lane) * 16 + 8 + h] + p.in[I_MLIB][l * 4 + h]; }
    __syncthreads();
    const float blast = bs[63];
    { const int i = tid >> 3, jb = tid & 7; const float bi = bs[i];
      { const float e = __expf(bi) * 0.125f; float o[8];
#pragma unroll
        for (int x = 0; x < 8; ++x) o[x] = qs[i * 65 + 8 * jb + x] * e;
        v4u w; w.x = pk2(o[0], o[1]); w.y = pk2(o[2], o[3]); w.z = pk2(o[4], o[5]); w.w = pk2(o[6], o[7]); *(v4u*)(MQ + i * 64 + 8 * jb) = w; }
      {
          const int ti = wave >> 1, c16 = lane & 15, g4 = lane >> 4, i2 = 16 * ti + c16; const float bi2 = bs[i2];
#define ML_F8(dst, base) do { const LAS float* _b = (base); const v4u _w = (v4u){pg8::cvt_pk_bf16(_b[0], _b[1]), pg8::cvt_pk_bf16(_b[2], _b[3]), pg8::cvt_pk_bf16(_b[4], _b[5]), pg8::cvt_pk_bf16(_b[6], _b[7])}; dst = __builtin_bit_cast(bf16x8_t, _w); } while (0)
          bf16x8_t bq[2];
#pragma unroll
          for (int s2 = 0; s2 < 2; ++s2) ML_F8(bq[s2], qs + i2 * 65 + 32 * s2 + 8 * g4);
#pragma unroll
          for (int jj = 0; jj < 2; ++jj) { const int tj = 2 * (wave & 1) + jj; v2u sw = (v2u){0u, 0u};
              if (tj <= ti) { pg8::f32x4 d = {0.f, 0.f, 0.f, 0.f};
#pragma unroll
                  for (int s2 = 0; s2 < 2; ++s2) { bf16x8_t a; ML_F8(a, ks + (16 * tj + c16) * 65 + 32 * s2 + 8 * g4); d = __builtin_amdgcn_mfma_f32_16x16x32_bf16(a, bq[s2], d, 0, 0, 0); }
                  float v4[4];
#pragma unroll
                  for (int r = 0; r < 4; ++r) { const int j = 16 * tj + 4 * g4 + r; v4[r] = (j <= i2) ? __expf(bi2 - bs[j] + bs[64 + j]) * d[r] * 0.125f : 0.f; }
                  sw = (v2u){pk2(v4[0], v4[1]), pk2(v4[2], v4[3])}; }
              *(v2u*)(MS + i2 * 64 + 16 * tj + 4 * g4) = sw; }
#undef ML_F8
      }
      { float o[8];
#pragma unroll
        for (int x = 0; x < 8; ++x) { const int j = 8 * jb + x; o[x] = ks[j * 65 + i] * __expf(blast - bs[j] + bs[64 + j]); }
        v4u w; w.x = pk2(o[0], o[1]); w.y = pk2(o[2], o[3]); w.z = pk2(o[4], o[5]); w.w = pk2(o[6], o[7]); *(v4u*)(MK + i * 64 + 8 * jb) = w; }
    }
    { const int c = tid >> 2, jq = tid & 3; unsigned w[8];
#pragma unroll
      for (int x = 0; x < 8; ++x) w[x] = (unsigned)vs[(16 * jq + 2 * x) * 136 + c] | ((unsigned)vs[(16 * jq + 2 * x + 1) * 136 + c] << 16);
      *(v4u*)(MV + c * 64 + 16 * jq) = (v4u){w[0], w[1], w[2], w[3]}; *(v4u*)(MV + c * 64 + 16 * jq + 8) = (v4u){w[4], w[5], w[6], w[7]};
      if (tid < 64) { const int c2 = 128 + (tid >> 2); const unsigned one = (c2 == 128) ? 0x3F803F80u : 0u;
          *(v4u*)(MV + c2 * 64 + 16 * jq) = (v4u){one, one, one, one}; *(v4u*)(MV + c2 * 64 + 16 * jq + 8) = (v4u){one, one, one, one}; } }
    if (tid == 0) MFL[item] = __expf(blast);
    __syncthreads();
}
struct MlFrags { bf16x8_t q[2], s[2], kt[2], vt[2]; float fl; };
__device__ __forceinline__ void ml_load(MlFrags& F, const Params& p, int item, int offA, int offV) {
    const bf16* MQ = (const bf16*)(p.ws + WS_MQ) + (size_t)item * 4096; const bf16* MS = (const bf16*)(p.ws + WS_MS) + (size_t)item * 4096; const bf16* MK = (const bf16*)(p.ws + WS_MK) + (size_t)item * 4096;
    const bf16* MV = (const bf16*)(p.ws + WS_MV) + (size_t)item * 9216;
#pragma unroll
    for (int ks = 0; ks < 2; ++ks) { F.q[ks] = *(const bf16x8_t*)(MQ + offA + 32 * ks); F.s[ks] = *(const bf16x8_t*)(MS + offA + 32 * ks); F.kt[ks] = *(const bf16x8_t*)(MK + offA + 32 * ks); F.vt[ks] = *(const bf16x8_t*)(MV + offV + 32 * ks); }
    F.fl = ((const float*)(p.ws + WS_MFL))[item];
}
__device__ __forceinline__ void ml_seq(const Params& p, LAS unsigned char* lds, int wgi, int wave, int lane) {
    const int u = wgi * 2 + (wave >> 2), wi = wave & 3, h = u / 9, sl = u % 9, g = lane >> 4, c = lane & 15;
    LAS unsigned short* CT = (LAS unsigned short*)(lds + (wave >> 2) * 4096);
    float* HO = (float*)(p.ws + WS_HO); float* HDEN = (float*)(p.ws + WS_HDEN);
    const int offA = (16 * wi + c) * 64 + 8 * g, offV = (16 * sl + c) * 64 + 8 * g;
    *(LAS v2u*)(CT + c * 64 + 16 * wi + 4 * g) = (v2u){0u, 0u};
    pg8::f32x4 Cacc = {0.f, 0.f, 0.f, 0.f};
    __syncthreads();
    MlFrags F0, F1;
    ml_load(F0, p, h, offA, offV);
#define ML_STEP(F, n_) do { const int cur = (n_) & 1; \
        const bf16x8_t c0 = *(const LAS bf16x8_t*)(CT + cur * 1024 + c * 64 + 8 * g), c1 = *(const LAS bf16x8_t*)(CT + cur * 1024 + c * 64 + 32 + 8 * g); \
        pg8::f32x4 num = {0.f, 0.f, 0.f, 0.f}; \
        num = __builtin_amdgcn_mfma_f32_16x16x32_bf16(F.q[0], c0, num, 0, 0, 0); num = __builtin_amdgcn_mfma_f32_16x16x32_bf16(F.q[1], c1, num, 0, 0, 0); \
        num = __builtin_amdgcn_mfma_f32_16x16x32_bf16(F.s[0], F.vt[0], num, 0, 0, 0); num = __builtin_amdgcn_mfma_f32_16x16x32_bf16(F.s[1], F.vt[1], num, 0, 0, 0); \
        Cacc = Cacc * F.fl; \
        Cacc = __builtin_amdgcn_mfma_f32_16x16x32_bf16(F.kt[0], F.vt[0], Cacc, 0, 0, 0); Cacc = __builtin_amdgcn_mfma_f32_16x16x32_bf16(F.kt[1], F.vt[1], Cacc, 0, 0, 0); \
        { v2u w; w.x = pk2(Cacc[0], Cacc[1]); w.y = pk2(Cacc[2], Cacc[3]); *(LAS v2u*)(CT + (cur ^ 1) * 1024 + c * 64 + 16 * wi + 4 * g) = w; } \
        { const size_t tb = (size_t)(n_) * 64 + 16 * wi + 4 * g; \
          if (sl < 8) { _Pragma("unroll") for (int r = 0; r < 4; ++r) HO[(tb + r) * BW + h * 128 + 16 * sl + c] = num[r]; } \
          else if (c == 0) { _Pragma("unroll") for (int r = 0; r < 4; ++r) HDEN[(tb + r) * 4 + h] = num[r]; } } \
        LDS_BAR(); } while (0)
    for (int n = 0; n < T / 64; n += 2) {
        ml_load(F1, p, (n + 1) * 4 + h, offA, offV);
        ML_STEP(F0, n);
        ml_load(F0, p, ((n + 2 < T / 64) ? n + 2 : n) * 4 + h, offA, offV);
        ML_STEP(F1, n + 1);
    }
#undef ML_STEP
}


constexpr int QP = 132;
__device__ __forceinline__ void gdn_pre_item(const Params& p, int l, LAS unsigned char* lds, int item, int tid, int wave, int lane) {
    const int h = item & 3, n = item >> 2; const size_t t0 = (size_t)n * 64;
    const bf16* Z = (const bf16*)(p.ws + WS_Z); const float* SMALL = (const float*)(p.ws + WS_SMALL);
    float* GU = (float*)(p.ws + WS_GU) + (size_t)item * 8192; bf16* GNW = (bf16*)(p.ws + WS_GNW) + (size_t)item * 8192; bf16* GQG = (bf16*)(p.ws + WS_GQG) + (size_t)item * 8192;
    bf16* GAT = (bf16*)(p.ws + WS_GAT) + (size_t)item * 4096; bf16* GKT = (bf16*)(p.ws + WS_GKT) + (size_t)item * 8192; float* GDL = (float*)(p.ws + WS_GDL);
    const float* cw = p.in[I_CONVW] + (size_t)l * 4 * 1536;
    LAS float* qs = (LAS float*)lds; LAS float* ks = qs + 64 * QP; LAS float* vs = ks + 64 * QP; LAS float* Ls = vs + 64 * QP;   LAS float* gcs = Ls + 64 * 68; LAS float* bts = gcs + 64; LAS float* btg = bts + 64;
    LAS unsigned short* zq = (LAS unsigned short*)(lds + 131584); LAS unsigned short* zk = (LAS unsigned short*)Ls; LAS unsigned short* zv = (LAS unsigned short*)vs; LAS float* cwl = btg + 64;
    float gate_b = 0.f, gate_a = 0.f; if (wave == 0) { gate_b = SMALL[(t0 + lane) * 16 + h]; gate_a = SMALL[(t0 + lane) * 16 + 4 + h]; }
    {   v4u zr[7]; v4f wr4 = (v4f){0.f, 0.f, 0.f, 0.f};
#pragma unroll
        for (int q = 0; q < 7; ++q) { const int idx = tid + 512 * q; zr[q] = (v4u){0u, 0u, 0u, 0u};
            if (idx < 3216) { const int seg = idx / 1072, rem = idx % 1072, r = rem >> 4, c16 = rem & 15; const long tt = (long)t0 - 3 + r;
                if (tt >= 0) zr[q] = *(const v4u*)(Z + (size_t)tt * ZC + ZC_GDN + seg * 512 + h * 128 + 8 * c16); } }
        if (tid < 384) { const int j = tid / 96, rest = tid % 96, i = rest >> 5, c4 = rest & 31; wr4 = *(const v4f*)(cw + j * 1536 + i * 512 + h * 128 + 4 * c4); }
#pragma unroll
        for (int q = 0; q < 7; ++q) { const int idx = tid + 512 * q;
            if (idx < 3216) { const int seg = idx / 1072, rem = idx % 1072; LAS unsigned short* zb = seg == 0 ? zq : (seg == 1 ? zk : zv); *(LAS v4u*)(zb + 8 * rem) = zr[q]; } }
        if (tid < 384) *(LAS v4f*)(cwl + 4 * tid) = wr4;
    }
    __syncthreads();
    { const int tk = tid >> 3, part = tid & 7; float av[16];
#pragma unroll 1
      for (int i = 0; i < 3; ++i) { float a[16]; const LAS unsigned short* zb = i == 0 ? zq : (i == 1 ? zk : zv);
#pragma unroll
        for (int x = 0; x < 16; ++x) a[x] = 0.f;
#pragma unroll
        for (int j = 0; j < 4; ++j) { const LAS unsigned short* src = zb + (tk + j) * 128 + 16 * part; float x0[8], x1[8]; unpack8(*(const LAS v4u*)src, x0); unpack8(*(const LAS v4u*)(src + 8), x1);
            const LAS float* wp = cwl + (j * 3 + i) * 128 + 16 * part;
#pragma unroll
            for (int x4 = 0; x4 < 2; ++x4) { const v4f w0 = *(const LAS v4f*)(wp + 4 * x4), w1 = *(const LAS v4f*)(wp + 8 + 4 * x4);
                a[4 * x4] += w0.x * x0[4 * x4]; a[4 * x4 + 1] += w0.y * x0[4 * x4 + 1]; a[4 * x4 + 2] += w0.z * x0[4 * x4 + 2]; a[4 * x4 + 3] += w0.w * x0[4 * x4 + 3];
                a[8 + 4 * x4] += w1.x * x1[4 * x4]; a[8 + 4 * x4 + 1] += w1.y * x1[4 * x4 + 1]; a[8 + 4 * x4 + 2] += w1.z * x1[4 * x4 + 2]; a[8 + 4 * x4 + 3] += w1.w * x1[4 * x4 + 3]; } }
        float ss = 0.f;
#pragma unroll
        for (int x = 0; x < 16; ++x) { a[x] = siluf_(a[x]); ss += a[x] * a[x]; }
        if (i < 2) { ss = sum8(ss); const float r = rsqrtf(ss + 1e-6f) * (i == 0 ? 0.08838834764831845f : 1.f);
#pragma unroll
            for (int x = 0; x < 16; ++x) a[x] *= r;
            LAS float* dst = (i == 0 ? qs : ks) + tk * QP + 16 * part;
#pragma unroll
            for (int x4 = 0; x4 < 4; ++x4) *(LAS v4f*)(dst + 4 * x4) = (v4f){a[4 * x4], a[4 * x4 + 1], a[4 * x4 + 2], a[4 * x4 + 3]}; }
        else {
#pragma unroll
            for (int x = 0; x < 16; ++x) av[x] = a[x]; } }
      __syncthreads();
      { LAS float* dst = vs + tk * QP + 16 * part;
#pragma unroll
        for (int x4 = 0; x4 < 4; ++x4) *(LAS v4f*)(dst + 4 * x4) = (v4f){av[4 * x4], av[4 * x4 + 1], av[4 * x4 + 2], av[4 * x4 + 3]}; } }
    if (wave == 0) { const float bb = gate_b, aa = gate_a;
        const float g = -__expf(p.in[I_ALOG][l * 4 + h]) * softplusf_(aa + p.in[I_DTB][l * 4 + h]);
        const float gc = wave_scan_incl(g), bt = sigmoidf_(bb); gcs[lane] = gc; bts[lane] = bt; btg[lane] = bt * __expf(gc); }
    __syncthreads();
    { const int ti = wave >> 1, c16 = lane & 15, g4 = lane >> 4, i = 16 * ti + c16; const float gi = gcs[i], bi = bts[i];
#define GDN_F8(dst, base) do { const v4f _a = *(const LAS v4f*)(base), _b = *(const LAS v4f*)((base) + 4); const v4u _w = (v4u){pg8::cvt_pk_bf16(_a.x, _a.y), pg8::cvt_pk_bf16(_a.z, _a.w), pg8::cvt_pk_bf16(_b.x, _b.y), pg8::cvt_pk_bf16(_b.z, _b.w)}; dst = __builtin_bit_cast(bf16x8_t, _w); } while (0)
      bf16x8_t bk[4], bq[4];
#pragma unroll
      for (int s4 = 0; s4 < 4; ++s4) { GDN_F8(bk[s4], ks + i * QP + 32 * s4 + 8 * g4); GDN_F8(bq[s4], qs + i * QP + 32 * s4 + 8 * g4); }
#pragma unroll
      for (int jj = 0; jj < 2; ++jj) { const int tj = 2 * (wave & 1) + jj; v4f lv = (v4f){0.f, 0.f, 0.f, 0.f}; v2u aw = (v2u){0u, 0u};
          if (tj <= ti) { pg8::f32x4 dk = {0.f, 0.f, 0.f, 0.f}, dq = {0.f, 0.f, 0.f, 0.f};
#pragma unroll
              for (int s4 = 0; s4 < 4; ++s4) { bf16x8_t a; GDN_F8(a, ks + (16 * tj + c16) * QP + 32 * s4 + 8 * g4);
                  dk = __builtin_amdgcn_mfma_f32_16x16x32_bf16(a, bk[s4], dk, 0, 0, 0); dq = __builtin_amdgcn_mfma_f32_16x16x32_bf16(a, bq[s4], dq, 0, 0, 0); }
              float l4[4], a4[4];
#pragma unroll
              for (int r = 0; r < 4; ++r) { const int j = 16 * tj + 4 * g4 + r; const float dc = __expf(gi - gcs[j]); l4[r] = (j < i) ? bi * dk[r] * dc : 0.f; a4[r] = (j <= i) ? dq[r] * dc : 0.f; }
              lv = (v4f){l4[0], l4[1], l4[2], l4[3]}; aw = (v2u){pk2(a4[0], a4[1]), pk2(a4[2], a4[3])}; }
          *(LAS v4f*)(Ls + i * 68 + 16 * tj + 4 * g4) = lv; *(v2u*)(GAT + i * 64 + 16 * tj + 4 * g4) = aw; }
#undef GDN_F8
    }
    __syncthreads();
    if (tid < 256) {
        const int c = tid; int vz; asm volatile("v_mov_b32 %0, 0" : "=v"(vz));
        const LAS float* rp = (c < 128) ? (vs + c) : (ks + (c - 128)); const LAS float* mp = ((c < 128) ? bts : btg) + vz;
#define GDN_RHS(i) (rp[(i) * QP] * mp[(i)])
#define GDN_L4(i, j4) (*(const LAS v4f*)(Ls + (i) * 68 + 4 * (j4) + vz))
        float x0 = GDN_RHS(0); __builtin_amdgcn_sched_barrier(0);
        float x1 = GDN_RHS(1); { const v4f l0 = GDN_L4(1, 0); __builtin_amdgcn_sched_barrier(0); x1 -= l0.x * x0; } __builtin_amdgcn_sched_barrier(0);
        float x2 = GDN_RHS(2); { const v4f l0 = GDN_L4(2, 0); __builtin_amdgcn_sched_barrier(0); x2 -= l0.x * x0; x2 -= l0.y * x1; } __builtin_amdgcn_sched_barrier(0);
        float x3 = GDN_RHS(3); { const v4f l0 = GDN_L4(3, 0); __builtin_amdgcn_sched_barrier(0); x3 -= l0.x * x0; x3 -= l0.y * x1; x3 -= l0.z * x2; } __builtin_amdgcn_sched_barrier(0);
        float x4 = GDN_RHS(4); { const v4f l0 = GDN_L4(4, 0); __builtin_amdgcn_sched_barrier(0); x4 -= l0.x * x0; x4 -= l0.y * x1; x4 -= l0.z * x2; x4 -= l0.w * x3; } __builtin_amdgcn_sched_barrier(0);
        float x5 = GDN_RHS(5); { const v4f l0 = GDN_L4(5, 0); const v4f l1 = GDN_L4(5, 1); __builtin_amdgcn_sched_barrier(0); x5 -= l0.x * x0; x5 -= l0.y * x1; x5 -= l0.z * x2; x5 -= l0.w * x3; x5 -= l1.x * x4; } __builtin_amdgcn_sched_barrier(0);
        float x6 = GDN_RHS(6); { const v4f l0 = GDN_L4(6, 0); const v4f l1 = GDN_L4(6, 1); __builtin_amdgcn_sched_barrier(0); x6 -= l0.x * x0; x6 -= l0.y * x1; x6 -= l0.z * x2; x6 -= l0.w * x3; x6 -= l1.x * x4; x6 -= l1.y * x5; } __builtin_amdgcn_sched_barrier(0);
        float x7 = GDN_RHS(7); { const v4f l0 = GDN_L4(7, 0); const v4f l1 = GDN_L4(7, 1); __builtin_amdgcn_sched_barrier(0); x7 -= l0.x * x0; x7 -= l0.y * x1; x7 -= l0.z * x2; x7 -= l0.w * x3; x7 -= l1.x * x4; x7 -= l1.y * x5; x7 -= l1.z * x6; } __builtin_amdgcn_sched_barrier(0);
        float x8 = GDN_RHS(8); { const v4f l0 = GDN_L4(8, 0); const v4f l1 = GDN_L4(8, 1); __builtin_amdgcn_sched_barrier(0); x8 -= l0.x * x0; x8 -= l0.y * x1; x8 -= l0.z * x2; x8 -= l0.w * x3; x8 -= l1.x * x4; x8 -= l1.y * x5; x8 -= l1.z * x6; x8 -= l1.w * x7; } __builtin_amdgcn_sched_barrier(0);
        float x9 = GDN_RHS(9); { const v4f l0 = GDN_L4(9, 0); const v4f l1 = GDN_L4(9, 1); const v4f l2 = GDN_L4(9, 2); __builtin_amdgcn_sched_barrier(0); x9 -= l0.x * x0; x9 -= l0.y * x1; x9 -= l0.z * x2; x9 -= l0.w * x3; x9 -= l1.x * x4; x9 -= l1.y * x5; x9 -= l1.z * x6; x9 -= l1.w * x7; x9 -= l2.x * x8; } __builtin_amdgcn_sched_barrier(0);
        float x10 = GDN_RHS(10); { const v4f l0 = GDN_L4(10, 0); const v4f l1 = GDN_L4(10, 1); const v4f l2 = GDN_L4(10, 2); __builtin_amdgcn_sched_barrier(0); x10 -= l0.x * x0; x10 -= l0.y * x1; x10 -= l0.z * x2; x10 -= l0.w * x3; x10 -= l1.x * x4; x10 -= l1.y * x5; x10 -= l1.z * x6; x10 -= l1.w * x7; x10 -= l2.x * x8; x10 -= l2.y * x9; } __builtin_amdgcn_sched_barrier(0);
        float x11 = GDN_RHS(11); { const v4f l0 = GDN_L4(11, 0); const v4f l1 = GDN_L4(11, 1); const v4f l2 = GDN_L4(11, 2); __builtin_amdgcn_sched_barrier(0); x11 -= l0.x * x0; x11 -= l0.y * x1; x11 -= l0.z * x2; x11 -= l0.w * x3; x11 -= l1.x * x4; x11 -= l1.y * x5; x11 -= l1.z * x6; x11 -= l1.w * x7; x11 -= l2.x * x8; x11 -= l2.y * x9; x11 -= l2.z * x10; } __builtin_amdgcn_sched_barrier(0);
        float x12 = GDN_RHS(12); { const v4f l0 = GDN_L4(12, 0); const v4f l1 = GDN_L4(12, 1); const v4f l2 = GDN_L4(12, 2); __builtin_amdgcn_sched_barrier(0); x12 -= l0.x * x0; x12 -= l0.y * x1; x12 -= l0.z * x2; x12 -= l0.w * x3; x12 -= l1.x * x4; x12 -= l1.y * x5; x12 -= l1.z * x6; x12 -= l1.w * x7; x12 -= l2.x * x8; x12 -= l2.y * x9; x12 -= l2.z * x10; x12 -= l2.w * x11; } __builtin_amdgcn_sched_barrier(0);
        float x13 = GDN_RHS(13); { const v4f l0 = GDN_L4(13, 0); const v4f l1 = GDN_L4(13, 1); const v4f l2 = GDN_L4(13, 2); const v4f l3 = GDN_L4(13, 3); __builtin_amdgcn_sched_barrier(0); x13 -= l0.x * x0; x13 -= l0.y * x1; x13 -= l0.z * x2; x13 -= l0.w * x3; x13 -= l1.x * x4; x13 -= l1.y * x5; x13 -= l1.z * x6; x13 -= l1.w * x7; x13 -= l2.x * x8; x13 -= l2.y * x9; x13 -= l2.z * x10; x13 -= l2.w * x11; x13 -= l3.x * x12; } __builtin_amdgcn_sched_barrier(0);
        float x14 = GDN_RHS(14); { const v4f l0 = GDN_L4(14, 0); const v4f l1 = GDN_L4(14, 1); const v4f l2 = GDN_L4(14, 2); const v4f l3 = GDN_L4(14, 3); __builtin_amdgcn_sched_barrier(0); x14 -= l0.x * x0; x14 -= l0.y * x1; x14 -= l0.z * x2; x14 -= l0.w * x3; x14 -= l1.x * x4; x14 -= l1.y * x5; x14 -= l1.z * x6; x14 -= l1.w * x7; x14 -= l2.x * x8; x14 -= l2.y * x9; x14 -= l2.z * x10; x14 -= l2.w * x11; x14 -= l3.x * x12; x14 -= l3.y * x13; } __builtin_amdgcn_sched_barrier(0);
        float x15 = GDN_RHS(15); { const v4f l0 = GDN_L4(15, 0); const v4f l1 = GDN_L4(15, 1); const v4f l2 = GDN_L4(15, 2); const v4f l3 = GDN_L4(15, 3); __builtin_amdgcn_sched_barrier(0); x15 -= l0.x * x0; x15 -= l0.y * x1; x15 -= l0.z * x2; x15 -= l0.w * x3; x15 -= l1.x * x4; x15 -= l1.y * x5; x15 -= l1.z * x6; x15 -= l1.w * x7; x15 -= l2.x * x8; x15 -= l2.y * x9; x15 -= l2.z * x10; x15 -= l2.w * x11; x15 -= l3.x * x12; x15 -= l3.y * x13; x15 -= l3.z * x14; } __builtin_amdgcn_sched_barrier(0);
        float x16 = GDN_RHS(16); { const v4f l0 = GDN_L4(16, 0); const v4f l1 = GDN_L4(16, 1); const v4f l2 = GDN_L4(16, 2); const v4f l3 = GDN_L4(16, 3); __builtin_amdgcn_sched_barrier(0); x16 -= l0.x * x0; x16 -= l0.y * x1; x16 -= l0.z * x2; x16 -= l0.w * x3; x16 -= l1.x * x4; x16 -= l1.y * x5; x16 -= l1.z * x6; x16 -= l1.w * x7; x16 -= l2.x * x8; x16 -= l2.y * x9; x16 -= l2.z * x10; x16 -= l2.w * x11; x16 -= l3.x * x12; x16 -= l3.y * x13; x16 -= l3.z * x14; x16 -= l3.w * x15; } __builtin_amdgcn_sched_barrier(0);
        float x17 = GDN_RHS(17); { const v4f l0 = GDN_L4(17, 0); const v4f l1 = GDN_L4(17, 1); const v4f l2 = GDN_L4(17, 2); const v4f l3 = GDN_L4(17, 3); const v4f l4 = GDN_L4(17, 4); __builtin_amdgcn_sched_barrier(0); x17 -= l0.x * x0; x17 -= l0.y * x1; x17 -= l0.z * x2; x17 -= l0.w * x3; x17 -= l1.x * x4; x17 -= l1.y * x5; x17 -= l1.z * x6; x17 -= l1.w * x7; x17 -= l2.x * x8; x17 -= l2.y * x9; x17 -= l2.z * x10; x17 -= l2.w * x11; x17 -= l3.x * x12; x17 -= l3.y * x13; x17 -= l3.z * x14; x17 -= l3.w * x15; x17 -= l4.x * x16; } __builtin_amdgcn_sched_barrier(0);
        float x18 = GDN_RHS(18); { const v4f l0 = GDN_L4(18, 0); const v4f l1 = GDN_L4(18, 1); const v4f l2 = GDN_L4(18, 2); const v4f l3 = GDN_L4(18, 3); const v4f l4 = GDN_L4(18, 4); __builtin_amdgcn_sched_barrier(0); x18 -= l0.x * x0; x18 -= l0.y * x1; x18 -= l0.z * x2; x18 -= l0.w * x3; x18 -= l1.x * x4; x18 -= l1.y * x5; x18 -= l1.z * x6; x18 -= l1.w * x7; x18 -= l2.x * x8; x18 -= l2.y * x9; x18 -= l2.z * x10; x18 -= l2.w * x11; x18 -= l3.x * x12; x18 -= l3.y * x13; x18 -= l3.z * x14; x18 -= l3.w * x15; x18 -= l4.x * x16; x18 -= l4.y * x17; } __builtin_amdgcn_sched_barrier(0);
        float x19 = GDN_RHS(19); { const v4f l0 = GDN_L4(19, 0); const v4f l1 = GDN_L4(19, 1); const v4f l2 = GDN_L4(19, 2); const v4f l3 = GDN_L4(19, 3); const v4f l4 = GDN_L4(19, 4); __builtin_amdgcn_sched_barrier(0); x19 -= l0.x * x0; x19 -= l0.y * x1; x19 -= l0.z * x2; x19 -= l0.w * x3; x19 -= l1.x * x4; x19 -= l1.y * x5; x19 -= l1.z * x6; x19 -= l1.w * x7; x19 -= l2.x * x8; x19 -= l2.y * x9; x19 -= l2.z * x10; x19 -= l2.w * x11; x19 -= l3.x * x12; x19 -= l3.y * x13; x19 -= l3.z * x14; x19 -= l3.w * x15; x19 -= l4.x * x16; x19 -= l4.y * x17; x19 -= l4.z * x18; } __builtin_amdgcn_sched_barrier(0);
        float x20 = GDN_RHS(20); { const v4f l0 = GDN_L4(20, 0); const v4f l1 = GDN_L4(20, 1); const v4f l2 = GDN_L4(20, 2); const v4f l3 = GDN_L4(20, 3); const v4f l4 = GDN_L4(20, 4); __builtin_amdgcn_sched_barrier(0); x20 -= l0.x * x0; x20 -= l0.y * x1; x20 -= l0.z * x2; x20 -= l0.w * x3; x20 -= l1.x * x4; x20 -= l1.y * x5; x20 -= l1.z * x6; x20 -= l1.w * x7; x20 -= l2.x * x8; x20 -= l2.y * x9; x20 -= l2.z * x10; x20 -= l2.w * x11; x20 -= l3.x * x12; x20 -= l3.y * x13; x20 -= l3.z * x14; x20 -= l3.w * x15; x20 -= l4.x * x16; x20 -= l4.y * x17; x20 -= l4.z * x18; x20 -= l4.w * x19; } __builtin_amdgcn_sched_barrier(0);
        float x21 = GDN_RHS(21); { const v4f l0 = GDN_L4(21, 0); const v4f l1 = GDN_L4(21, 1); const v4f l2 = GDN_L4(21, 2); const v4f l3 = GDN_L4(21, 3); const v4f l4 = GDN_L4(21, 4); const v4f l5 = GDN_L4(21, 5); __builtin_amdgcn_sched_barrier(0); x21 -= l0.x * x0; x21 -= l0.y * x1; x21 -= l0.z * x2; x21 -= l0.w * x3; x21 -= l1.x * x4; x21 -= l1.y * x5; x21 -= l1.z * x6; x21 -= l1.w * x7; x21 -= l2.x * x8; x21 -= l2.y * x9; x21 -= l2.z * x10; x21 -= l2.w * x11; x21 -= l3.x * x12; x21 -= l3.y * x13; x21 -= l3.z * x14; x21 -= l3.w * x15; x21 -= l4.x * x16; x21 -= l4.y * x17; x21 -= l4.z * x18; x21 -= l4.w * x19; x21 -= l5.x * x20; } __builtin_amdgcn_sched_barrier(0);
        float x22 = GDN_RHS(22); { const v4f l0 = GDN_L4(22, 0); const v4f l1 = GDN_L4(22, 1); const v4f l2 = GDN_L4(22, 2); const v4f l3 = GDN_L4(22, 3); const v4f l4 = GDN_L4(22, 4); const v4f l5 = GDN_L4(22, 5); __builtin_amdgcn_sched_barrier(0); x22 -= l0.x * x0; x22 -= l0.y * x1; x22 -= l0.z * x2; x22 -= l0.w * x3; x22 -= l1.x * x4; x22 -= l1.y * x5; x22 -= l1.z * x6; x22 -= l1.w * x7; x22 -= l2.x * x8; x22 -= l2.y * x9; x22 -= l2.z * x10; x22 -= l2.w * x11; x22 -= l3.x * x12; x22 -= l3.y * x13; x22 -= l3.z * x14; x22 -= l3.w * x15; x22 -= l4.x * x16; x22 -= l4.y * x17; x22 -= l4.z * x18; x22 -= l4.w * x19; x22 -= l5.x * x20; x22 -= l5.y * x21; } __builtin_amdgcn_sched_barrier(0);
        float x23 = GDN_RHS(23); { const v4f l0 = GDN_L4(23, 0); const v4f l1 = GDN_L4(23, 1); const v4f l2 = GDN_L4(23, 2); const v4f l3 = GDN_L4(23, 3); const v4f l4 = GDN_L4(23, 4); const v4f l5 = GDN_L4(23, 5); __builtin_amdgcn_sched_barrier(0); x23 -= l0.x * x0; x23 -= l0.y * x1; x23 -= l0.z * x2; x23 -= l0.w * x3; x23 -= l1.x * x4; x23 -= l1.y * x5; x23 -= l1.z * x6; x23 -= l1.w * x7; x23 -= l2.x * x8; x23 -= l2.y * x9; x23 -= l2.z * x10; x23 -= l2.w * x11; x23 -= l3.x * x12; x23 -= l3.y * x13; x23 -= l3.z * x14; x23 -= l3.w * x15; x23 -= l4.x * x16; x23 -= l4.y * x17; x23 -= l4.z * x18; x23 -= l4.w * x19; x23 -= l5.x * x20; x23 -= l5.y * x21; x23 -= l5.z * x22; } __builtin_amdgcn_sched_barrier(0);
        float x24 = GDN_RHS(24); { const v4f l0 = GDN_L4(24, 0); const v4f l1 = GDN_L4(24, 1); const v4f l2 = GDN_L4(24, 2); const v4f l3 = GDN_L4(24, 3); const v4f l4 = GDN_L4(24, 4); const v4f l5 = GDN_L4(24, 5); __builtin_amdgcn_sched_barrier(0); x24 -= l0.x * x0; x24 -= l0.y * x1; x24 -= l0.z * x2; x24 -= l0.w * x3; x24 -= l1.x * x4; x24 -= l1.y * x5; x24 -= l1.z * x6; x24 -= l1.w * x7; x24 -= l2.x * x8; x24 -= l2.y * x9; x24 -= l2.z * x10; x24 -= l2.w * x11; x24 -= l3.x * x12; x24 -= l3.y * x13; x24 -= l3.z * x14; x24 -= l3.w * x15; x24 -= l4.x * x16; x24 -= l4.y * x17; x24 -= l4.z * x18; x24 -= l4.w * x19; x24 -= l5.x * x20; x24 -= l5.y * x21; x24 -= l5.z * x22; x24 -= l5.w * x23; } __builtin_amdgcn_sched_barrier(0);
        float x25 = GDN_RHS(25); { const v4f l0 = GDN_L4(25, 0); const v4f l1 = GDN_L4(25, 1); const v4f l2 = GDN_L4(25, 2); const v4f l3 = GDN_L4(25, 3); const v4f l4 = GDN_L4(25, 4); const v4f l5 = GDN_L4(25, 5); __builtin_amdgcn_sched_barrier(0); x25 -= l0.x * x0; x25 -= l0.y * x1; x25 -= l0.z * x2; x25 -= l0.w * x3; x25 -= l1.x * x4; x25 -= l1.y * x5; x25 -= l1.z * x6; x25 -= l1.w * x7; x25 -= l2.x * x8; x25 -= l2.y * x9; x25 -= l2.z * x10; x25 -= l2.w * x11; x25 -= l3.x * x12; x25 -= l3.y * x13; x25 -= l3.z * x14; x25 -= l3.w * x15; x25 -= l4.x * x16; x25 -= l4.y * x17; x25 -= l4.z * x18; x25 -= l4.w * x19; x25 -= l5.x * x20; x25 -= l5.y * x21; x25 -= l5.z * x22; x25 -= l5.w * x23; } __builtin_amdgcn_sched_barrier(0); { const v4f l6 = GDN_L4(25, 6); __builtin_amdgcn_sched_barrier(0); x25 -= l6.x * x24; } __builtin_amdgcn_sched_barrier(0);
        float x26 = GDN_RHS(26); { const v4f l0 = GDN_L4(26, 0); const v4f l1 = GDN_L4(26, 1); const v4f l2 = GDN_L4(26, 2); const v4f l3 = GDN_L4(26, 3); const v4f l4 = GDN_L4(26, 4); const v4f l5 = GDN_L4(26, 5); __builtin_amdgcn_sched_barrier(0); x26 -= l0.x * x0; x26 -= l0.y * x1; x26 -= l0.z * x2; x26 -= l0.w * x3; x26 -= l1.x * x4; x26 -= l1.y * x5; x26 -= l1.z * x6; x26 -= l1.w * x7; x26 -= l2.x * x8; x26 -= l2.y * x9; x26 -= l2.z * x10; x26 -= l2.w * x11; x26 -= l3.x * x12; x26 -= l3.y * x13; x26 -= l3.z * x14; x26 -= l3.w * x15; x26 -= l4.x * x16; x26 -= l4.y * x17; x26 -= l4.z * x18; x26 -= l4.w * x19; x26 -= l5.x * x20; x26 -= l5.y * x21; x26 -= l5.z * x22; x26 -= l5.w * x23; } __builtin_amdgcn_sched_barrier(0); { const v4f l6 = GDN_L4(26, 6); __builtin_amdgcn_sched_barrier(0); x26 -= l6.x * x24; x26 -= l6.y * x25; } __builtin_amdgcn_sched_barrier(0);
        float x27 = GDN_RHS(27); { const v4f l0 = GDN_L4(27, 0); const v4f l1 = GDN_L4(27, 1); const v4f l2 = GDN_L4(27, 2); const v4f l3 = GDN_L4(27, 3); const v4f l4 = GDN_L4(27, 4); const v4f l5 = GDN_L4(27, 5); __builtin_amdgcn_sched_barrier(0); x27 -= l0.x * x0; x27 -= l0.y * x1; x27 -= l0.z * x2; x27 -= l0.w * x3; x27 -= l1.x * x4; x27 -= l1.y * x5; x27 -= l1.z * x6; x27 -= l1.w * x7; x27 -= l2.x * x8; x27 -= l2.y * x9; x27 -= l2.z * x10; x27 -= l2.w * x11; x27 -= l3.x * x12; x27 -= l3.y * x13; x27 -= l3.z * x14; x27 -= l3.w * x15; x27 -= l4.x * x16; x27 -= l4.y * x17; x27 -= l4.z * x18; x27 -= l4.w * x19; x27 -= l5.x * x20; x27 -= l5.y * x21; x27 -= l5.z * x22; x27 -= l5.w * x23; } __builtin_amdgcn_sched_barrier(0); { const v4f l6 = GDN_L4(27, 6); __builtin_amdgcn_sched_barrier(0); x27 -= l6.x * x24; x27 -= l6.y * x25; x27 -= l6.z * x26; } __builtin_amdgcn_sched_barrier(0);
        float x28 = GDN_RHS(28); { const v4f l0 = GDN_L4(28, 0); const v4f l1 = GDN_L4(28, 1); const v4f l2 = GDN_L4(28, 2); const v4f l3 = GDN_L4(28, 3); const v4f l4 = GDN_L4(28, 4); const v4f l5 = GDN_L4(28, 5); __builtin_amdgcn_sched_barrier(0); x28 -= l0.x * x0; x28 -= l0.y * x1; x28 -= l0.z * x2; x28 -= l0.w * x3; x28 -= l1.x * x4; x28 -= l1.y * x5; x28 -= l1.z * x6; x28 -= l1.w * x7; x28 -= l2.x * x8; x28 -= l2.y * x9; x28 -= l2.z * x10; x28 -= l2.w * x11; x28 -= l3.x * x12; x28 -= l3.y * x13; x28 -= l3.z * x14; x28 -= l3.w * x15; x28 -= l4.x * x16; x28 -= l4.y * x17; x28 -= l4.z * x18; x28 -= l4.w * x19; x28 -= l5.x * x20; x28 -= l5.y * x21; x28 -= l5.z * x22; x28 -= l5.w * x23; } __builtin_amdgcn_sched_barrier(0); { const v4f l6 = GDN_L4(28, 6); __builtin_amdgcn_sched_barrier(0); x28 -= l6.x * x24; x28 -= l6.y * x25; x28 -= l6.z * x26; x28 -= l6.w * x27; } __builtin_amdgcn_sched_barrier(0);
        float x29 = GDN_RHS(29); { const v4f l0 = GDN_L4(29, 0); const v4f l1 = GDN_L4(29, 1); const v4f l2 = GDN_L4(29, 2); const v4f l3 = GDN_L4(29, 3); const v4f l4 = GDN_L4(29, 4); const v4f l5 = GDN_L4(29, 5); __builtin_amdgcn_sched_barrier(0); x29 -= l0.x * x0; x29 -= l0.y * x1; x29 -= l0.z * x2; x29 -= l0.w * x3; x29 -= l1.x * x4; x29 -= l1.y * x5; x29 -= l1.z * x6; x29 -= l1.w * x7; x29 -= l2.x * x8; x29 -= l2.y * x9; x29 -= l2.z * x10; x29 -= l2.w * x11; x29 -= l3.x * x12; x29 -= l3.y * x13; x29 -= l3.z * x14; x29 -= l3.w * x15; x29 -= l4.x * x16; x29 -= l4.y * x17; x29 -= l4.z * x18; x29 -= l4.w * x19; x29 -= l5.x * x20; x29 -= l5.y * x21; x29 -= l5.z * x22; x29 -= l5.w * x23; } __builtin_amdgcn_sched_barrier(0); { const v4f l6 = GDN_L4(29, 6); const v4f l7 = GDN_L4(29, 7); __builtin_amdgcn_sched_barrier(0); x29 -= l6.x * x24; x29 -= l6.y * x25; x29 -= l6.z * x26; x29 -= l6.w * x27; x29 -= l7.x * x28; } __builtin_amdgcn_sched_barrier(0);
        float x30 = GDN_RHS(30); { const v4f l0 = GDN_L4(30, 0); const v4f l1 = GDN_L4(30, 1); const v4f l2 = GDN_L4(30, 2); const v4f l3 = GDN_L4(30, 3); const v4f l4 = GDN_L4(30, 4); const v4f l5 = GDN_L4(30, 5); __builtin_amdgcn_sched_barrier(0); x30 -= l0.x * x0; x30 -= l0.y * x1; x30 -= l0.z * x2; x30 -= l0.w * x3; x30 -= l1.x * x4; x30 -= l1.y * x5; x30 -= l1.z * x6; x30 -= l1.w * x7; x30 -= l2.x * x8; x30 -= l2.y * x9; x30 -= l2.z * x10; x30 -= l2.w * x11; x30 -= l3.x * x12; x30 -= l3.y * x13; x30 -= l3.z * x14; x30 -= l3.w * x15; x30 -= l4.x * x16; x30 -= l4.y * x17; x30 -= l4.z * x18; x30 -= l4.w * x19; x30 -= l5.x * x20; x30 -= l5.y * x21; x30 -= l5.z * x22; x30 -= l5.w * x23; } __builtin_amdgcn_sched_barrier(0); { const v4f l6 = GDN_L4(30, 6); const v4f l7 = GDN_L4(30, 7); __builtin_amdgcn_sched_barrier(0); x30 -= l6.x * x24; x30 -= l6.y * x25; x30 -= l6.z * x26; x30 -= l6.w * x27; x30 -= l7.x * x28; x30 -= l7.y * x29; } __builtin_amdgcn_sched_barrier(0);
        float x31 = GDN_RHS(31); { const v4f l0 = GDN_L4(31, 0); const v4f l1 = GDN_L4(31, 1); const v4f l2 = GDN_L4(31, 2); const v4f l3 = GDN_L4(31, 3); const v4f l4 = GDN_L4(31, 4); const v4f l5 = GDN_L4(31, 5); __builtin_amdgcn_sched_barrier(0); x31 -= l0.x * x0; x31 -= l0.y * x1; x31 -= l0.z * x2; x31 -= l0.w * x3; x31 -= l1.x * x4; x31 -= l1.y * x5; x31 -= l1.z * x6; x31 -= l1.w * x7; x31 -= l2.x * x8; x31 -= l2.y * x9; x31 -= l2.z * x10; x31 -= l2.w * x11; x31 -= l3.x * x12; x31 -= l3.y * x13; x31 -= l3.z * x14; x31 -= l3.w * x15; x31 -= l4.x * x16; x31 -= l4.y * x17; x31 -= l4.z * x18; x31 -= l4.w * x19; x31 -= l5.x * x20; x31 -= l5.y * x21; x31 -= l5.z * x22; x31 -= l5.w * x23; } __builtin_amdgcn_sched_barrier(0); { const v4f l6 = GDN_L4(31, 6); const v4f l7 = GDN_L4(31, 7); __builtin_amdgcn_sched_barrier(0); x31 -= l6.x * x24; x31 -= l6.y * x25; x31 -= l6.z * x26; x31 -= l6.w * x27; x31 -= l7.x * x28; x31 -= l7.y * x29; x31 -= l7.z * x30; } __builtin_amdgcn_sched_barrier(0);
        float x32 = GDN_RHS(32); { const v4f l0 = GDN_L4(32, 0); const v4f l1 = GDN_L4(32, 1); const v4f l2 = GDN_L4(32, 2); const v4f l3 = GDN_L4(32, 3); const v4f l4 = GDN_L4(32, 4); const v4f l5 = GDN_L4(32, 5); __builtin_amdgcn_sched_barrier(0); x32 -= l0.x * x0; x32 -= l0.y * x1; x32 -= l0.z * x2; x32 -= l0.w * x3; x32 -= l1.x * x4; x32 -= l1.y * x5; x32 -= l1.z * x6; x32 -= l1.w * x7; x32 -= l2.x * x8; x32 -= l2.y * x9; x32 -= l2.z * x10; x32 -= l2.w * x11; x32 -= l3.x * x12; x32 -= l3.y * x13; x32 -= l3.z * x14; x32 -= l3.w * x15; x32 -= l4.x * x16; x32 -= l4.y * x17; x32 -= l4.z * x18; x32 -= l4.w * x19; x32 -= l5.x * x20; x32 -= l5.y * x21; x32 -= l5.z * x22; x32 -= l5.w * x23; } __builtin_amdgcn_sched_barrier(0); { const v4f l6 = GDN_L4(32, 6); const v4f l7 = GDN_L4(32, 7); __builtin_amdgcn_sched_barrier(0); x32 -= l6.x * x24; x32 -= l6.y * x25; x32 -= l6.z * x26; x32 -= l6.w * x27; x32 -= l7.x * x28; x32 -= l7.y * x29; x32 -= l7.z * x30; x32 -= l7.w * x31; } __builtin_amdgcn_sched_barrier(0);
        float x33 = GDN_RHS(33); { const v4f l0 = GDN_L4(33, 0); const v4f l1 = GDN_L4(33, 1); const v4f l2 = GDN_L4(33, 2); const v4f l3 = GDN_L4(33, 3); const v4f l4 = GDN_L4(33, 4); const v4f l5 = GDN_L4(33, 5); __builtin_amdgcn_sched_barrier(0); x33 -= l0.x * x0; x33 -= l0.y * x1; x33 -= l0.z * x2; x33 -= l0.w * x3; x33 -= l1.x * x4; x33 -= l1.y * x5; x33 -= l1.z * x6; x33 -= l1.w * x7; x33 -= l2.x * x8; x33 -= l2.y * x9; x33 -= l2.z * x10; x33 -= l2.w * x11; x33 -= l3.x * x12; x33 -= l3.y * x13; x33 -= l3.z * x14; x33 -= l3.w * x15; x33 -= l4.x * x16; x33 -= l4.y * x17; x33 -= l4.z * x18; x33 -= l4.w * x19; x33 -= l5.x * x20; x33 -= l5.y * x21; x33 -= l5.z * x22; x33 -= l5.w * x23; } __builtin_amdgcn_sched_barrier(0); { const v4f l6 = GDN_L4(33, 6); const v4f l7 = GDN_L4(33, 7); const v4f l8 = GDN_L4(33, 8); __builtin_amdgcn_sched_barrier(0); x33 -= l6.x * x24; x33 -= l6.y * x25; x33 -= l6.z * x26; x33 -= l6.w * x27; x33 -= l7.x * x28; x33 -= l7.y * x29; x33 -= l7.z * x30; x33 -= l7.w * x31; x33 -= l8.x * x32; } __builtin_amdgcn_sched_barrier(0);
        float x34 = GDN_RHS(34); { const v4f l0 = GDN_L4(34, 0); const v4f l1 = GDN_L4(34, 1); const v4f l2 = GDN_L4(34, 2); const v4f l3 = GDN_L4(34, 3); const v4f l4 = GDN_L4(34, 4); const v4f l5 = GDN_L4(34, 5); __builtin_amdgcn_sched_barrier(0); x34 -= l0.x * x0; x34 -= l0.y * x1; x34 -= l0.z * x2; x34 -= l0.w * x3; x34 -= l1.x * x4; x34 -= l1.y * x5; x34 -= l1.z * x6; x34 -= l1.w * x7; x34 -= l2.x * x8; x34 -= l2.y * x9; x34 -= l2.z * x10; x34 -= l2.w * x11; x34 -= l3.x * x12; x34 -= l3.y * x13; x34 -= l3.z * x14; x34 -= l3.w * x15; x34 -= l4.x * x16; x34 -= l4.y * x17; x34 -= l4.z * x18; x34 -= l4.w * x19; x34 -= l5.x * x20; x34 -= l5.y * x21; x34 -= l5.z * x22; x34 -= l5.w * x23; } __builtin_amdgcn_sched_barrier(0); { const v4f l6 = GDN_L4(34, 6); const v4f l7 = GDN_L4(34, 7); const v4f l8 = GDN_L4(34, 8); __builtin_amdgcn_sched_barrier(0); x34 -= l6.x * x24; x34 -= l6.y * x25; x34 -= l6.z * x26; x34 -= l6.w * x27; x34 -= l7.x * x28; x34 -= l7.y * x29; x34 -= l7.z * x30; x34 -= l7.w * x31; x34 -= l8.x * x32; x34 -= l8.y * x33; } __builtin_amdgcn_sched_barrier(0);
        float x35 = GDN_RHS(35); { const v4f l0 = GDN_L4(35, 0); const v4f l1 = GDN_L4(35, 1); const v4f l2 = GDN_L4(35, 2); const v4f l3 = GDN_L4(35, 3); const v4f l4 = GDN_L4(35, 4); const v4f l5 = GDN_L4(35, 5); __builtin_amdgcn_sched_barrier(0); x35 -= l0.x * x0; x35 -= l0.y * x1; x35 -= l0.z * x2; x35 -= l0.w * x3; x35 -= l1.x * x4; x35 -= l1.y * x5; x35 -= l1.z * x6; x35 -= l1.w * x7; x35 -= l2.x * x8; x35 -= l2.y * x9; x35 -= l2.z * x10; x35 -= l2.w * x11; x35 -= l3.x * x12; x35 -= l3.y * x13; x35 -= l3.z * x14; x35 -= l3.w * x15; x35 -= l4.x * x16; x35 -= l4.y * x17; x35 -= l4.z * x18; x35 -= l4.w * x19; x35 -= l5.x * x20; x35 -= l5.y * x21; x35 -= l5.z * x22; x35 -= l5.w * x23; } __builtin_amdgcn_sched_barrier(0); { const v4f l6 = GDN_L4(35, 6); const v4f l7 = GDN_L4(35, 7); const v4f l8 = GDN_L4(35, 8); __builtin_amdgcn_sched_barrier(0); x35 -= l6.x * x24; x35 -= l6.y * x25; x35 -= l6.z * x26; x35 -= l6.w * x27; x35 -= l7.x * x28; x35 -= l7.y * x29; x35 -= l7.z * x30; x35 -= l7.w * x31; x35 -= l8.x * x32; x35 -= l8.y * x33; x35 -= l8.z * x34; } __builtin_amdgcn_sched_barrier(0);
        float x36 = GDN_RHS(36); { const v4f l0 = GDN_L4(36, 0); const v4f l1 = GDN_L4(36, 1); const v4f l2 = GDN_L4(36, 2); const v4f l3 = GDN_L4(36, 3); const v4f l4 = GDN_L4(36, 4); const v4f l5 = GDN_L4(36, 5); __builtin_amdgcn_sched_barrier(0); x36 -= l0.x * x0; x36 -= l0.y * x1; x36 -= l0.z * x2; x36 -= l0.w * x3; x36 -= l1.x * x4; x36 -= l1.y * x5; x36 -= l1.z * x6; x36 -= l1.w * x7; x36 -= l2.x * x8; x36 -= l2.y * x9; x36 -= l2.z * x10; x36 -= l2.w * x11; x36 -= l3.x * x12; x36 -= l3.y * x13; x36 -= l3.z * x14; x36 -= l3.w * x15; x36 -= l4.x * x16; x36 -= l4.y * x17; x36 -= l4.z * x18; x36 -= l4.w * x19; x36 -= l5.x * x20; x36 -= l5.y * x21; x36 -= l5.z * x22; x36 -= l5.w * x23; } __builtin_amdgcn_sched_barrier(0); { const v4f l6 = GDN_L4(36, 6); const v4f l7 = GDN_L4(36, 7); const v4f l8 = GDN_L4(36, 8); __builtin_amdgcn_sched_barrier(0); x36 -= l6.x * x24; x36 -= l6.y * x25; x36 -= l6.z * x26; x36 -= l6.w * x27; x36 -= l7.x * x28; x36 -= l7.y * x29; x36 -= l7.z * x30; x36 -= l7.w * x31; x36 -= l8.x * x32; x36 -= l8.y * x33; x36 -= l8.z * x34; x36 -= l8.w * x35; } __builtin_amdgcn_sched_barrier(0);
        float x37 = GDN_RHS(37); { const v4f l0 = GDN_L4(37, 0); const v4f l1 = GDN_L4(37, 1); const v4f l2 = GDN_L4(37, 2); const v4f l3 = GDN_L4(37, 3); const v4f l4 = GDN_L4(37, 4); const v4f l5 = GDN_L4(37, 5); __builtin_amdgcn_sched_barrier(0); x37 -= l0.x * x0; x37 -= l0.y * x1; x37 -= l0.z * x2; x37 -= l0.w * x3; x37 -= l1.x * x4; x37 -= l1.y * x5; x37 -= l1.z * x6; x37 -= l1.w * x7; x37 -= l2.x * x8; x37 -= l2.y * x9; x37 -= l2.z * x10; x37 -= l2.w * x11; x37 -= l3.x * x12; x37 -= l3.y * x13; x37 -= l3.z * x14; x37 -= l3.w * x15; x37 -= l4.x * x16; x37 -= l4.y * x17; x37 -= l4.z * x18; x37 -= l4.w * x19; x37 -= l5.x * x20; x37 -= l5.y * x21; x37 -= l5.z * x22; x37 -= l5.w * x23; } __builtin_amdgcn_sched_barrier(0); { const v4f l6 = GDN_L4(37, 6); const v4f l7 = GDN_L4(37, 7); const v4f l8 = GDN_L4(37, 8); const v4f l9 = GDN_L4(37, 9); __builtin_amdgcn_sched_barrier(0); x37 -= l6.x * x24; x37 -= l6.y * x25; x37 -= l6.z * x26; x37 -= l6.w * x27; x37 -= l7.x * x28; x37 -= l7.y * x29; x37 -= l7.z * x30; x37 -= l7.w * x31; x37 -= l8.x * x32; x37 -= l8.y * x33; x37 -= l8.z * x34; x37 -= l8.w * x35; x37 -= l9.x * x36; } __builtin_amdgcn_sched_barrier(0);
        float x38 = GDN_RHS(38); { const v4f l0 = GDN_L4(38, 0); const v4f l1 = GDN_L4(38, 1); const v4f l2 = GDN_L4(38, 2); const v4f l3 = GDN_L4(38, 3); const v4f l4 = GDN_L4(38, 4); const v4f l5 = GDN_L4(38, 5); __builtin_amdgcn_sched_barrier(0); x38 -= l0.x * x0; x38 -= l0.y * x1; x38 -= l0.z * x2; x38 -= l0.w * x3; x38 -= l1.x * x4; x38 -= l1.y * x5; x38 -= l1.z * x6; x38 -= l1.w * x7; x38 -= l2.x * x8; x38 -= l2.y * x9; x38 -= l2.z * x10; x38 -= l2.w * x11; x38 -= l3.x * x12; x38 -= l3.y * x13; x38 -= l3.z * x14; x38 -= l3.w * x15; x38 -= l4.x * x16; x38 -= l4.y * x17; x38 -= l4.z * x18; x38 -= l4.w * x19; x38 -= l5.x * x20; x38 -= l5.y * x21; x38 -= l5.z * x22; x38 -= l5.w * x23; } __builtin_amdgcn_sched_barrier(0); { const v4f l6 = GDN_L4(38, 6); const v4f l7 = GDN_L4(38, 7); const v4f l8 = GDN_L4(38, 8); const v4f l9 = GDN_L4(38, 9); __builtin_amdgcn_sched_barrier(0); x38 -= l6.x * x24; x38 -= l6.y * x25; x38 -= l6.z * x26; x38 -= l6.w * x27; x38 -= l7.x * x28; x38 -= l7.y * x29; x38 -= l7.z * x30; x38 -= l7.w * x31; x38 -= l8.x * x32; x38 -= l8.y * x33; x38 -= l8.z * x34; x38 -= l8.w * x35; x38 -= l9.x * x36; x38 -= l9.y * x37; } __builtin_amdgcn_sched_barrier(0);
        float x39 = GDN_RHS(39); { const v4f l0 = GDN_L4(39, 0); const v4f l1 = GDN_L4(39, 1); const v4f l2 = GDN_L4(39, 2); const v4f l3 = GDN_L4(39, 3); const v4f l4 = GDN_L4(39, 4); const v4f l5 = GDN_L4(39, 5); __builtin_amdgcn_sched_barrier(0); x39 -= l0.x * x0; x39 -= l0.y * x1; x39 -= l0.z * x2; x39 -= l0.w * x3; x39 -= l1.x * x4; x39 -= l1.y * x5; x39 -= l1.z * x6; x39 -= l1.w * x7; x39 -= l2.x * x8; x39 -= l2.y * x9; x39 -= l2.z * x10; x39 -= l2.w * x11; x39 -= l3.x * x12; x39 -= l3.y * x13; x39 -= l3.z * x14; x39 -= l3.w * x15; x39 -= l4.x * x16; x39 -= l4.y * x17; x39 -= l4.z * x18; x39 -= l4.w * x19; x39 -= l5.x * x20; x39 -= l5.y * x21; x39 -= l5.z * x22; x39 -= l5.w * x23; } __builtin_amdgcn_sched_barrier(0); { const v4f l6 = GDN_L4(39, 6); const v4f l7 = GDN_L4(39, 7); const v4f l8 = GDN_L4(39, 8); const v4f l9 = GDN_L4(39, 9); __builtin_amdgcn_sched_barrier(0); x39 -= l6.x * x24; x39 -= l6.y * x25; x39 -= l6.z * x26; x39 -= l6.w * x27; x39 -= l7.x * x28; x39 -= l7.y * x29; x39 -= l7.z * x30; x39 -= l7.w * x31; x39 -= l8.x * x32; x39 -= l8.y * x33; x39 -= l8.z * x34; x39 -= l8.w * x35; x39 -= l9.x * x36; x39 -= l9.y * x37; x39 -= l9.z * x38; } __builtin_amdgcn_sched_barrier(0);
        float x40 = GDN_RHS(40); { const v4f l0 = GDN_L4(40, 0); const v4f l1 = GDN_L4(40, 1); const v4f l2 = GDN_L4(40, 2); const v4f l3 = GDN_L4(40, 3); const v4f l4 = GDN_L4(40, 4); const v4f l5 = GDN_L4(40, 5); __builtin_amdgcn_sched_barrier(0); x40 -= l0.x * x0; x40 -= l0.y * x1; x40 -= l0.z * x2; x40 -= l0.w * x3; x40 -= l1.x * x4; x40 -= l1.y * x5; x40 -= l1.z * x6; x40 -= l1.w * x7; x40 -= l2.x * x8; x40 -= l2.y * x9; x40 -= l2.z * x10; x40 -= l2.w * x11; x40 -= l3.x * x12; x40 -= l3.y * x13; x40 -= l3.z * x14; x40 -= l3.w * x15; x40 -= l4.x * x16; x40 -= l4.y * x17; x40 -= l4.z * x18; x40 -= l4.w * x19; x40 -= l5.x * x20; x40 -= l5.y * x21; x40 -= l5.z * x22; x40 -= l5.w * x23; } __builtin_amdgcn_sched_barrier(0); { const v4f l6 = GDN_L4(40, 6); const v4f l7 = GDN_L4(40, 7); const v4f l8 = GDN_L4(40, 8); const v4f l9 = GDN_L4(40, 9); __builtin_amdgcn_sched_barrier(0); x40 -= l6.x * x24; x40 -= l6.y * x25; x40 -= l6.z * x26; x40 -= l6.w * x27; x40 -= l7.x * x28; x40 -= l7.y * x29; x40 -= l7.z * x30; x40 -= l7.w * x31; x40 -= l8.x * x32; x40 -= l8.y * x33; x40 -= l8.z * x34; x40 -= l8.w * x35; x40 -= l9.x * x36; x40 -= l9.y * x37; x40 -= l9.z * x38; x40 -= l9.w * x39; } __builtin_amdgcn_sched_barrier(0);
        float x41 = GDN_RHS(41); { const v4f l0 = GDN_L4(41, 0); const v4f l1 = GDN_L4(41, 1); const v4f l2 = GDN_L4(41, 2); const v4f l3 = GDN_L4(41, 3); const v4f l4 = GDN_L4(41, 4); const v4f l5 = GDN_L4(41, 5); __builtin_amdgcn_sched_barrier(0); x41 -= l0.x * x0; x41 -= l0.y * x1; x41 -= l0.z * x2; x41 -= l0.w * x3; x41 -= l1.x * x4; x41 -= l1.y * x5; x41 -= l1.z * x6; x41 -= l1.w * x7; x41 -= l2.x * x8; x41 -= l2.y * x9; x41 -= l2.z * x10; x41 -= l2.w * x11; x41 -= l3.x * x12; x41 -= l3.y * x13; x41 -= l3.z * x14; x41 -= l3.w * x15; x41 -= l4.x * x16; x41 -= l4.y * x17; x41 -= l4.z * x18; x41 -= l4.w * x19; x41 -= l5.x * x20; x41 -= l5.y * x21; x41 -= l5.z * x22; x41 -= l5.w * x23; } __builtin_amdgcn_sched_barrier(0); { const v4f l6 = GDN_L4(41, 6); const v4f l7 = GDN_L4(41, 7); const v4f l8 = GDN_L4(41, 8); const v4f l9 = GDN_L4(41, 9); const v4f l10 = GDN_L4(41, 10); __builtin_amdgcn_sched_barrier(0); x41 -= l6.x * x24; x41 -= l6.y * x25; x41 -= l6.z * x26; x41 -= l6.w * x27; x41 -= l7.x * x28; x41 -= l7.y * x29; x41 -= l7.z * x30; x41 -= l7.w * x31; x41 -= l8.x * x32; x41 -= l8.y * x33; x41 -= l8.z * x34; x41 -= l8.w * x35; x41 -= l9.x * x36; x41 -= l9.y * x37; x41 -= l9.z * x38; x41 -= l9.w * x39; x41 -= l10.x * x40; } __builtin_amdgcn_sched_barrier(0);
        float x42 = GDN_RHS(42); { const v4f l0 = GDN_L4(42, 0); const v4f l1 = GDN_L4(42, 1); const v4f l2 = GDN_L4(42, 2); const v4f l3 = GDN_L4(42, 3); const v4f l4 = GDN_L4(42, 4); const v4f l5 = GDN_L4(42, 5); __builtin_amdgcn_sched_barrier(0); x42 -= l0.x * x0; x42 -= l0.y * x1; x42 -= l0.z * x2; x42 -= l0.w * x3; x42 -= l1.x * x4; x42 -= l1.y * x5; x42 -= l1.z * x6; x42 -= l1.w * x7; x42 -= l2.x * x8; x42 -= l2.y * x9; x42 -= l2.z * x10; x42 -= l2.w * x11; x42 -= l3.x * x12; x42 -= l3.y * x13; x42 -= l3.z * x14; x42 -= l3.w * x15; x42 -= l4.x * x16; x42 -= l4.y * x17; x42 -= l4.z * x18; x42 -= l4.w * x19; x42 -= l5.x * x20; x42 -= l5.y * x21; x42 -= l5.z * x22; x42 -= l5.w * x23; } __builtin_amdgcn_sched_barrier(0); { const v4f l6 = GDN_L4(42, 6); const v4f l7 = GDN_L4(42, 7); const v4f l8 = GDN_L4(42, 8); const v4f l9 = GDN_L4(42, 9); const v4f l10 = GDN_L4(42, 10); __builtin_amdgcn_sched_barrier(0); x42 -= l6.x * x24; x42 -= l6.y * x25; x42 -= l6.z * x26; x42 -= l6.w * x27; x42 -= l7.x * x28; x42 -= l7.y * x29; x42 -= l7.z * x30; x42 -= l7.w * x31; x42 -= l8.x * x32; x42 -= l8.y * x33; x42 -= l8.z * x34; x42 -= l8.w * x35; x42 -= l9.x * x36; x42 -= l9.y * x37; x42 -= l9.z * x38; x42 -= l9.w * x39; x42 -= l10.x * x40; x42 -= l10.y * x41; } __builtin_amdgcn_sched_barrier(0);
        float x43 = GDN_RHS(43); { const v4f l0 = GDN_L4(43, 0); const v4f l1 = GDN_L4(43, 1); const v4f l2 = GDN_L4(43, 2); const v4f l3 = GDN_L4(43, 3); const v4f l4 = GDN_L4(43, 4); const v4f l5 = GDN_L4(43, 5); __builtin_amdgcn_sched_barrier(0); x43 -= l0.x * x0; x43 -= l0.y * x1; x43 -= l0.z * x2; x43 -= l0.w * x3; x43 -= l1.x * x4; x43 -= l1.y * x5; x43 -= l1.z * x6; x43 -= l1.w * x7; x43 -= l2.x * x8; x43 -= l2.y * x9; x43 -= l2.z * x10; x43 -= l2.w * x11; x43 -= l3.x * x12; x43 -= l3.y * x13; x43 -= l3.z * x14; x43 -= l3.w * x15; x43 -= l4.x * x16; x43 -= l4.y * x17; x43 -= l4.z * x18; x43 -= l4.w * x19; x43 -= l5.x * x20; x43 -= l5.y * x21; x43 -= l5.z * x22; x43 -= l5.w * x23; } __builtin_amdgcn_sched_barrier(0); { const v4f l6 = GDN_L4(43, 6); const v4f l7 = GDN_L4(43, 7); const v4f l8 = GDN_L4(43, 8); const v4f l9 = GDN_L4(43, 9); const v4f l10 = GDN_L4(43, 10); __builtin_amdgcn_sched_barrier(0); x43 -= l6.x * x24; x43 -= l6.y * x25; x43 -= l6.z * x26; x43 -= l6.w * x27; x43 -= l7.x * x28; x43 -= l7.y * x29; x43 -= l7.z * x30; x43 -= l7.w * x31; x43 -= l8.x * x32; x43 -= l8.y * x33; x43 -= l8.z * x34; x43 -= l8.w * x35; x43 -= l9.x * x36; x43 -= l9.y * x37; x43 -= l9.z * x38; x43 -= l9.w * x39; x43 -= l10.x * x40; x43 -= l10.y * x41; x43 -= l10.z * x42; } __builtin_amdgcn_sched_barrier(0);
        float x44 = GDN_RHS(44); { const v4f l0 = GDN_L4(44, 0); const v4f l1 = GDN_L4(44, 1); const v4f l2 = GDN_L4(44, 2); const v4f l3 = GDN_L4(44, 3); const v4f l4 = GDN_L4(44, 4); const v4f l5 = GDN_L4(44, 5); __builtin_amdgcn_sched_barrier(0); x44 -= l0.x * x0; x44 -= l0.y * x1; x44 -= l0.z * x2; x44 -= l0.w * x3; x44 -= l1.x * x4; x44 -= l1.y * x5; x44 -= l1.z * x6; x44 -= l1.w * x7; x44 -= l2.x * x8; x44 -= l2.y * x9; x44 -= l2.z * x10; x44 -= l2.w * x11; x44 -= l3.x * x12; x44 -= l3.y * x13; x44 -= l3.z * x14; x44 -= l3.w * x15; x44 -= l4.x * x16; x44 -= l4.y * x17; x44 -= l4.z * x18; x44 -= l4.w * x19; x44 -= l5.x * x20; x44 -= l5.y * x21; x44 -= l5.z * x22; x44 -= l5.w * x23; } __builtin_amdgcn_sched_barrier(0); { const v4f l6 = GDN_L4(44, 6); const v4f l7 = GDN_L4(44, 7); const v4f l8 = GDN_L4(44, 8); const v4f l9 = GDN_L4(44, 9); const v4f l10 = GDN_L4(44, 10); __builtin_amdgcn_sched_barrier(0); x44 -= l6.x * x24; x44 -= l6.y * x25; x44 -= l6.z * x26; x44 -= l6.w * x27; x44 -= l7.x * x28; x44 -= l7.y * x29; x44 -= l7.z * x30; x44 -= l7.w * x31; x44 -= l8.x * x32; x44 -= l8.y * x33; x44 -= l8.z * x34; x44 -= l8.w * x35; x44 -= l9.x * x36; x44 -= l9.y * x37; x44 -= l9.z * x38; x44 -= l9.w * x39; x44 -= l10.x * x40; x44 -= l10.y * x41; x44 -= l10.z * x42; x44 -= l10.w * x43; } __builtin_amdgcn_sched_barrier(0);
        float x45 = GDN_RHS(45); { const v4f l0 = GDN_L4(45, 0); const v4f l1 = GDN_L4(45, 1); const v4f l2 = GDN_L4(45, 2); const v4f l3 = GDN_L4(45, 3); const v4f l4 = GDN_L4(45, 4); const v4f l5 = GDN_L4(45, 5); __builtin_amdgcn_sched_barrier(0); x45 -= l0.x * x0; x45 -= l0.y * x1; x45 -= l0.z * x2; x45 -= l0.w * x3; x45 -= l1.x * x4; x45 -= l1.y * x5; x45 -= l1.z * x6; x45 -= l1.w * x7; x45 -= l2.x * x8; x45 -= l2.y * x9; x45 -= l2.z * x10; x45 -= l2.w * x11; x45 -= l3.x * x12; x45 -= l3.y * x13; x45 -= l3.z * x14; x45 -= l3.w * x15; x45 -= l4.x * x16; x45 -= l4.y * x17; x45 -= l4.z * x18; x45 -= l4.w * x19; x45 -= l5.x * x20; x45 -= l5.y * x21; x45 -= l5.z * x22; x45 -= l5.w * x23; } __builtin_amdgcn_sched_barrier(0); { const v4f l6 = GDN_L4(45, 6); const v4f l7 = GDN_L4(45, 7); const v4f l8 = GDN_L4(45, 8); const v4f l9 = GDN_L4(45, 9); const v4f l10 = GDN_L4(45, 10); const v4f l11 = GDN_L4(45, 11); __builtin_amdgcn_sched_barrier(0); x45 -= l6.x * x24; x45 -= l6.y * x25; x45 -= l6.z * x26; x45 -= l6.w * x27; x45 -= l7.x * x28; x45 -= l7.y * x29; x45 -= l7.z * x30; x45 -= l7.w * x31; x45 -= l8.x * x32; x45 -= l8.y * x33; x45 -= l8.z * x34; x45 -= l8.w * x35; x45 -= l9.x * x36; x45 -= l9.y * x37; x45 -= l9.z * x38; x45 -= l9.w * x39; x45 -= l10.x * x40; x45 -= l10.y * x41; x45 -= l10.z * x42; x45 -= l10.w * x43; x45 -= l11.x * x44; } __builtin_amdgcn_sched_barrier(0);
        float x46 = GDN_RHS(46); { const v4f l0 = GDN_L4(46, 0); const v4f l1 = GDN_L4(46, 1); const v4f l2 = GDN_L4(46, 2); const v4f l3 = GDN_L4(46, 3); const v4f l4 = GDN_L4(46, 4); const v4f l5 = GDN_L4(46, 5); __builtin_amdgcn_sched_barrier(0); x46 -= l0.x * x0; x46 -= l0.y * x1; x46 -= l0.z * x2; x46 -= l0.w * x3; x46 -= l1.x * x4; x46 -= l1.y * x5; x46 -= l1.z * x6; x46 -= l1.w * x7; x46 -= l2.x * x8; x46 -= l2.y * x9; x46 -= l2.z * x10; x46 -= l2.w * x11; x46 -= l3.x * x12; x46 -= l3.y * x13; x46 -= l3.z * x14; x46 -= l3.w * x15; x46 -= l4.x * x16; x46 -= l4.y * x17; x46 -= l4.z * x18; x46 -= l4.w * x19; x46 -= l5.x * x20; x46 -= l5.y * x21; x46 -= l5.z * x22; x46 -= l5.w * x23; } __builtin_amdgcn_sched_barrier(0); { const v4f l6 = GDN_L4(46, 6); const v4f l7 = GDN_L4(46, 7); const v4f l8 = GDN_L4(46, 8); const v4f l9 = GDN_L4(46, 9); const v4f l10 = GDN_L4(46, 10); const v4f l11 = GDN_L4(46, 11); __builtin_amdgcn_sched_barrier(0); x46 -= l6.x * x24; x46 -= l6.y * x25; x46 -= l6.z * x26; x46 -= l6.w * x27; x46 -= l7.x * x28; x46 -= l7.y * x29; x46 -= l7.z * x30; x46 -= l7.w * x31; x46 -= l8.x * x32; x46 -= l8.y * x33; x46 -= l8.z * x34; x46 -= l8.w * x35; x46 -= l9.x * x36; x46 -= l9.y * x37; x46 -= l9.z * x38; x46 -= l9.w * x39; x46 -= l10.x * x40; x46 -= l10.y * x41; x46 -= l10.z * x42; x46 -= l10.w * x43; x46 -= l11.x * x44; x46 -= l11.y * x45; } __builtin_amdgcn_sched_barrier(0);
        float x47 = GDN_RHS(47); { const v4f l0 = GDN_L4(47, 0); const v4f l1 = GDN_L4(47, 1); const v4f l2 = GDN_L4(47, 2); const v4f l3 = GDN_L4(47, 3); const v4f l4 = GDN_L4(47, 4); const v4f l5 = GDN_L4(47, 5); __builtin_amdgcn_sched_barrier(0); x47 -= l0.x * x0; x47 -= l0.y * x1; x47 -= l0.z * x2; x47 -= l0.w * x3; x47 -= l1.x * x4; x47 -= l1.y * x5; x47 -= l1.z * x6; x47 -= l1.w * x7; x47 -= l2.x * x8; x47 -= l2.y * x9; x47 -= l2.z * x10; x47 -= l2.w * x11; x47 -= l3.x * x12; x47 -= l3.y * x13; x47 -= l3.z * x14; x47 -= l3.w * x15; x47 -= l4.x * x16; x47 -= l4.y * x17; x47 -= l4.z * x18; x47 -= l4.w * x19; x47 -= l5.x * x20; x47 -= l5.y * x21; x47 -= l5.z * x22; x47 -= l5.w * x23; } __builtin_amdgcn_sched_barrier(0); { const v4f l6 = GDN_L4(47, 6); const v4f l7 = GDN_L4(47, 7); const v4f l8 = GDN_L4(47, 8); const v4f l9 = GDN_L4(47, 9); const v4f l10 = GDN_L4(47, 10); const v4f l11 = GDN_L4(47, 11); __builtin_amdgcn_sched_barrier(0); x47 -= l6.x * x24; x47 -= l6.y * x25; x47 -= l6.z * x26; x47 -= l6.w * x27; x47 -= l7.x * x28; x47 -= l7.y * x29; x47 -= l7.z * x30; x47 -= l7.w * x31; x47 -= l8.x * x32; x47 -= l8.y * x33; x47 -= l8.z * x34; x47 -= l8.w * x35; x47 -= l9.x * x36; x47 -= l9.y * x37; x47 -= l9.z * x38; x47 -= l9.w * x39; x47 -= l10.x * x40; x47 -= l10.y * x41; x47 -= l10.z * x42; x47 -= l10.w * x43; x47 -= l11.x * x44; x47 -= l11.y * x45; x47 -= l11.z * x46; } __builtin_amdgcn_sched_barrier(0);
        float x48 = GDN_RHS(48); { const v4f l0 = GDN_L4(48, 0); const v4f l1 = GDN_L4(48, 1); const v4f l2 = GDN_L4(48, 2); const v4f l3 = GDN_L4(48, 3); const v4f l4 = GDN_L4(48, 4); const v4f l5 = GDN_L4(48, 5); __builtin_amdgcn_sched_barrier(0); x48 -= l0.x * x0; x48 -= l0.y * x1; x48 -= l0.z * x2; x48 -= l0.w * x3; x48 -= l1.x * x4; x48 -= l1.y * x5; x48 -= l1.z * x6; x48 -= l1.w * x7; x48 -= l2.x * x8; x48 -= l2.y * x9; x48 -= l2.z * x10; x48 -= l2.w * x11; x48 -= l3.x * x12; x48 -= l3.y * x13; x48 -= l3.z * x14; x48 -= l3.w * x15; x48 -= l4.x * x16; x48 -= l4.y * x17; x48 -= l4.z * x18; x48 -= l4.w * x19; x48 -= l5.x * x20; x48 -= l5.y * x21; x48 -= l5.z * x22; x48 -= l5.w * x23; } __builtin_amdgcn_sched_barrier(0); { const v4f l6 = GDN_L4(48, 6); const v4f l7 = GDN_L4(48, 7); const v4f l8 = GDN_L4(48, 8); const v4f l9 = GDN_L4(48, 9); const v4f l10 = GDN_L4(48, 10); const v4f l11 = GDN_L4(48, 11); __builtin_amdgcn_sched_barrier(0); x48 -= l6.x * x24; x48 -= l6.y * x25; x48 -= l6.z * x26; x48 -= l6.w * x27; x48 -= l7.x * x28; x48 -= l7.y * x29; x48 -= l7.z * x30; x48 -= l7.w * x31; x48 -= l8.x * x32; x48 -= l8.y * x33; x48 -= l8.z * x34; x48 -= l8.w * x35; x48 -= l9.x * x36; x48 -= l9.y * x37; x48 -= l9.z * x38; x48 -= l9.w * x39; x48 -= l10.x * x40; x48 -= l10.y * x41; x48 -= l10.z * x42; x48 -= l10.w * x43; x48 -= l11.x * x44; x48 -= l11.y * x45; x48 -= l11.z * x46; x48 -= l11.w * x47; } __builtin_amdgcn_sched_barrier(0);
        float x49 = GDN_RHS(49); { const v4f l0 = GDN_L4(49, 0); const v4f l1 = GDN_L4(49, 1); const v4f l2 = GDN_L4(49, 2); const v4f l3 = GDN_L4(49, 3); const v4f l4 = GDN_L4(49, 4); const v4f l5 = GDN_L4(49, 5); __builtin_amdgcn_sched_barrier(0); x49 -= l0.x * x0; x49 -= l0.y * x1; x49 -= l0.z * x2; x49 -= l0.w * x3; x49 -= l1.x * x4; x49 -= l1.y * x5; x49 -= l1.z * x6; x49 -= l1.w * x7; x49 -= l2.x * x8; x49 -= l2.y * x9; x49 -= l2.z * x10; x49 -= l2.w * x11; x49 -= l3.x * x12; x49 -= l3.y * x13; x49 -= l3.z * x14; x49 -= l3.w * x15; x49 -= l4.x * x16; x49 -= l4.y * x17; x49 -= l4.z * x18; x49 -= l4.w * x19; x49 -= l5.x * x20; x49 -= l5.y * x21; x49 -= l5.z * x22; x49 -= l5.w * x23; } __builtin_amdgcn_sched_barrier(0); { const v4f l6 = GDN_L4(49, 6); const v4f l7 = GDN_L4(49, 7); const v4f l8 = GDN_L4(49, 8); const v4f l9 = GDN_L4(49, 9); const v4f l10 = GDN_L4(49, 10); const v4f l11 = GDN_L4(49, 11); __builtin_amdgcn_sched_barrier(0); x49 -= l6.x * x24; x49 -= l6.y * x25; x49 -= l6.z * x26; x49 -= l6.w * x27; x49 -= l7.x * x28; x49 -= l7.y * x29; x49 -= l7.z * x30; x49 -= l7.w * x31; x49 -= l8.x * x32; x49 -= l8.y * x33; x49 -= l8.z * x34; x49 -= l8.w * x35; x49 -= l9.x * x36; x49 -= l9.y * x37; x49 -= l9.z * x38; x49 -= l9.w * x39; x49 -= l10.x * x40; x49 -= l10.y * x41; x49 -= l10.z * x42; x49 -= l10.w * x43; x49 -= l11.x * x44; x49 -= l11.y * x45; x49 -= l11.z * x46; x49 -= l11.w * x47; } __builtin_amdgcn_sched_barrier(0); { const v4f l12 = GDN_L4(49, 12); __builtin_amdgcn_sched_barrier(0); x49 -= l12.x * x48; } __builtin_amdgcn_sched_barrier(0);
        float x50 = GDN_RHS(50); { const v4f l0 = GDN_L4(50, 0); const v4f l1 = GDN_L4(50, 1); const v4f l2 = GDN_L4(50, 2); const v4f l3 = GDN_L4(50, 3); const v4f l4 = GDN_L4(50, 4); const v4f l5 = GDN_L4(50, 5); __builtin_amdgcn_sched_barrier(0); x50 -= l0.x * x0; x50 -= l0.y * x1; x50 -= l0.z * x2; x50 -= l0.w * x3; x50 -= l1.x * x4; x50 -= l1.y * x5; x50 -= l1.z * x6; x50 -= l1.w * x7; x50 -= l2.x * x8; x50 -= l2.y * x9; x50 -= l2.z * x10; x50 -= l2.w * x11; x50 -= l3.x * x12; x50 -= l3.y * x13; x50 -= l3.z * x14; x50 -= l3.w * x15; x50 -= l4.x * x16; x50 -= l4.y * x17; x50 -= l4.z * x18; x50 -= l4.w * x19; x50 -= l5.x * x20; x50 -= l5.y * x21; x50 -= l5.z * x22; x50 -= l5.w * x23; } __builtin_amdgcn_sched_barrier(0); { const v4f l6 = GDN_L4(50, 6); const v4f l7 = GDN_L4(50, 7); const v4f l8 = GDN_L4(50, 8); const v4f l9 = GDN_L4(50, 9); const v4f l10 = GDN_L4(50, 10); const v4f l11 = GDN_L4(50, 11); __builtin_amdgcn_sched_barrier(0); x50 -= l6.x * x24; x50 -= l6.y * x25; x50 -= l6.z * x26; x50 -= l6.w * x27; x50 -= l7.x * x28; x50 -= l7.y * x29; x50 -= l7.z * x30; x50 -= l7.w * x31; x50 -= l8.x * x32; x50 -= l8.y * x33; x50 -= l8.z * x34; x50 -= l8.w * x35; x50 -= l9.x * x36; x50 -= l9.y * x37; x50 -= l9.z * x38; x50 -= l9.w * x39; x50 -= l10.x * x40; x50 -= l10.y * x41; x50 -= l10.z * x42; x50 -= l10.w * x43; x50 -= l11.x * x44; x50 -= l11.y * x45; x50 -= l11.z * x46; x50 -= l11.w * x47; } __builtin_amdgcn_sched_barrier(0); { const v4f l12 = GDN_L4(50, 12); __builtin_amdgcn_sched_barrier(0); x50 -= l12.x * x48; x50 -= l12.y * x49; } __builtin_amdgcn_sched_barrier(0);
        float x51 = GDN_RHS(51); { const v4f l0 = GDN_L4(51, 0); const v4f l1 = GDN_L4(51, 1); const v4f l2 = GDN_L4(51, 2); const v4f l3 = GDN_L4(51, 3); const v4f l4 = GDN_L4(51, 4); const v4f l5 = GDN_L4(51, 5); __builtin_amdgcn_sched_barrier(0); x51 -= l0.x * x0; x51 -= l0.y * x1; x51 -= l0.z * x2; x51 -= l0.w * x3; x51 -= l1.x * x4; x51 -= l1.y * x5; x51 -= l1.z * x6; x51 -= l1.w * x7; x51 -= l2.x * x8; x51 -= l2.y * x9; x51 -= l2.z * x10; x51 -= l2.w * x11; x51 -= l3.x * x12; x51 -= l3.y * x13; x51 -= l3.z * x14; x51 -= l3.w * x15; x51 -= l4.x * x16; x51 -= l4.y * x17; x51 -= l4.z * x18; x51 -= l4.w * x19; x51 -= l5.x * x20; x51 -= l5.y * x21; x51 -= l5.z * x22; x51 -= l5.w * x23; } __builtin_amdgcn_sched_barrier(0); { const v4f l6 = GDN_L4(51, 6); const v4f l7 = GDN_L4(51, 7); const v4f l8 = GDN_L4(51, 8); const v4f l9 = GDN_L4(51, 9); const v4f l10 = GDN_L4(51, 10); const v4f l11 = GDN_L4(51, 11); __builtin_amdgcn_sched_barrier(0); x51 -= l6.x * x24; x51 -= l6.y * x25; x51 -= l6.z * x26; x51 -= l6.w * x27; x51 -= l7.x * x28; x51 -= l7.y * x29; x51 -= l7.z * x30; x51 -= l7.w * x31; x51 -= l8.x * x32; x51 -= l8.y * x33; x51 -= l8.z * x34; x51 -= l8.w * x35; x51 -= l9.x * x36; x51 -= l9.y * x37; x51 -= l9.z * x38; x51 -= l9.w * x39; x51 -= l10.x * x40; x51 -= l10.y * x41; x51 -= l10.z * x42; x51 -= l10.w * x43; x51 -= l11.x * x44; x51 -= l11.y * x45; x51 -= l11.z * x46; x51 -= l11.w * x47; } __builtin_amdgcn_sched_barrier(0); { const v4f l12 = GDN_L4(51, 12); __builtin_amdgcn_sched_barrier(0); x51 -= l12.x * x48; x51 -= l12.y * x49; x51 -= l12.z * x50; } __builtin_amdgcn_sched_barrier(0);
        float x52 = GDN_RHS(52); { const v4f l0 = GDN_L4(52, 0); const v4f l1 = GDN_L4(52, 1); const v4f l2 = GDN_L4(52, 2); const v4f l3 = GDN_L4(52, 3); const v4f l4 = GDN_L4(52, 4); const v4f l5 = GDN_L4(52, 5); __builtin_amdgcn_sched_barrier(0); x52 -= l0.x * x0; x52 -= l0.y * x1; x52 -= l0.z * x2; x52 -= l0.w * x3; x52 -= l1.x * x4; x52 -= l1.y * x5; x52 -= l1.z * x6; x52 -= l1.w * x7; x52 -= l2.x * x8; x52 -= l2.y * x9; x52 -= l2.z * x10; x52 -= l2.w * x11; x52 -= l3.x * x12; x52 -= l3.y * x13; x52 -= l3.z * x14; x52 -= l3.w * x15; x52 -= l4.x * x16; x52 -= l4.y * x17; x52 -= l4.z * x18; x52 -= l4.w * x19; x52 -= l5.x * x20; x52 -= l5.y * x21; x52 -= l5.z * x22; x52 -= l5.w * x23; } __builtin_amdgcn_sched_barrier(0); { const v4f l6 = GDN_L4(52, 6); const v4f l7 = GDN_L4(52, 7); const v4f l8 = GDN_L4(52, 8); const v4f l9 = GDN_L4(52, 9); const v4f l10 = GDN_L4(52, 10); const v4f l11 = GDN_L4(52, 11); __builtin_amdgcn_sched_barrier(0); x52 -= l6.x * x24; x52 -= l6.y * x25; x52 -= l6.z * x26; x52 -= l6.w * x27; x52 -= l7.x * x28; x52 -= l7.y * x29; x52 -= l7.z * x30; x52 -= l7.w * x31; x52 -= l8.x * x32; x52 -= l8.y * x33; x52 -= l8.z * x34; x52 -= l8.w * x35; x52 -= l9.x * x36; x52 -= l9.y * x37; x52 -= l9.z * x38; x52 -= l9.w * x39; x52 -= l10.x * x40; x52 -= l10.y * x41; x52 -= l10.z * x42; x52 -= l10.w * x43; x52 -= l11.x * x44; x52 -= l11.y * x45; x52 -= l11.z * x46; x52 -= l11.w * x47; } __builtin_amdgcn_sched_barrier(0); { const v4f l12 = GDN_L4(52, 12); __builtin_amdgcn_sched_barrier(0); x52 -= l12.x * x48; x52 -= l12.y * x49; x52 -= l12.z * x50; x52 -= l12.w * x51; } __builtin_amdgcn_sched_barrier(0);
        float x53 = GDN_RHS(53); { const v4f l0 = GDN_L4(53, 0); const v4f l1 = GDN_L4(53, 1); const v4f l2 = GDN_L4(53, 2); const v4f l3 = GDN_L4(53, 3); const v4f l4 = GDN_L4(53, 4); const v4f l5 = GDN_L4(53, 5); __builtin_amdgcn_sched_barrier(0); x53 -= l0.x * x0; x53 -= l0.y * x1; x53 -= l0.z * x2; x53 -= l0.w * x3; x53 -= l1.x * x4; x53 -= l1.y * x5; x53 -= l1.z * x6; x53 -= l1.w * x7; x53 -= l2.x * x8; x53 -= l2.y * x9; x53 -= l2.z * x10; x53 -= l2.w * x11; x53 -= l3.x * x12; x53 -= l3.y * x13; x53 -= l3.z * x14; x53 -= l3.w * x15; x53 -= l4.x * x16; x53 -= l4.y * x17; x53 -= l4.z * x18; x53 -= l4.w * x19; x53 -= l5.x * x20; x53 -= l5.y * x21; x53 -= l5.z * x22; x53 -= l5.w * x23; } __builtin_amdgcn_sched_barrier(0); { const v4f l6 = GDN_L4(53, 6); const v4f l7 = GDN_L4(53, 7); const v4f l8 = GDN_L4(53, 8); const v4f l9 = GDN_L4(53, 9); const v4f l10 = GDN_L4(53, 10); const v4f l11 = GDN_L4(53, 11); __builtin_amdgcn_sched_barrier(0); x53 -= l6.x * x24; x53 -= l6.y * x25; x53 -= l6.z * x26; x53 -= l6.w * x27; x53 -= l7.x * x28; x53 -= l7.y * x29; x53 -= l7.z * x30; x53 -= l7.w * x31; x53 -= l8.x * x32; x53 -= l8.y * x33; x53 -= l8.z * x34; x53 -= l8.w * x35; x53 -= l9.x * x36; x53 -= l9.y * x37; x53 -= l9.z * x38; x53 -= l9.w * x39; x53 -= l10.x * x40; x53 -= l10.y * x41; x53 -= l10.z * x42; x53 -= l10.w * x43; x53 -= l11.x * x44; x53 -= l11.y * x45; x53 -= l11.z * x46; x53 -= l11.w * x47; } __builtin_amdgcn_sched_barrier(0); { const v4f l12 = GDN_L4(53, 12); const v4f l13 = GDN_L4(53, 13); __builtin_amdgcn_sched_barrier(0); x53 -= l12.x * x48; x53 -= l12.y * x49; x53 -= l12.z * x50; x53 -= l12.w * x51; x53 -= l13.x * x52; } __builtin_amdgcn_sched_barrier(0);
        float x54 = GDN_RHS(54); { const v4f l0 = GDN_L4(54, 0); const v4f l1 = GDN_L4(54, 1); const v4f l2 = GDN_L4(54, 2); const v4f l3 = GDN_L4(54, 3); const v4f l4 = GDN_L4(54, 4); const v4f l5 = GDN_L4(54, 5); __builtin_amdgcn_sched_barrier(0); x54 -= l0.x * x0; x54 -= l0.y * x1; x54 -= l0.z * x2; x54 -= l0.w * x3; x54 -= l1.x * x4; x54 -= l1.y * x5; x54 -= l1.z * x6; x54 -= l1.w * x7; x54 -= l2.x * x8; x54 -= l2.y * x9; x54 -= l2.z * x10; x54 -= l2.w * x11; x54 -= l3.x * x12; x54 -= l3.y * x13; x54 -= l3.z * x14; x54 -= l3.w * x15; x54 -= l4.x * x16; x54 -= l4.y * x17; x54 -= l4.z * x18; x54 -= l4.w * x19; x54 -= l5.x * x20; x54 -= l5.y * x21; x54 -= l5.z * x22; x54 -= l5.w * x23; } __builtin_amdgcn_sched_barrier(0); { const v4f l6 = GDN_L4(54, 6); const v4f l7 = GDN_L4(54, 7); const v4f l8 = GDN_L4(54, 8); const v4f l9 = GDN_L4(54, 9); const v4f l10 = GDN_L4(54, 10); const v4f l11 = GDN_L4(54, 11); __builtin_amdgcn_sched_barrier(0); x54 -= l6.x * x24; x54 -= l6.y * x25; x54 -= l6.z * x26; x54 -= l6.w * x27; x54 -= l7.x * x28; x54 -= l7.y * x29; x54 -= l7.z * x30; x54 -= l7.w * x31; x54 -= l8.x * x32; x54 -= l8.y * x33; x54 -= l8.z * x34; x54 -= l8.w * x35; x54 -= l9.x * x36; x54 -= l9.y * x37; x54 -= l9.z * x38; x54 -= l9.w * x39; x54 -= l10.x * x40; x54 -= l10.y * x41; x54 -= l10.z * x42; x54 -= l10.w * x43; x54 -= l11.x * x44; x54 -= l11.y * x45; x54 -= l11.z * x46; x54 -= l11.w * x47; } __builtin_amdgcn_sched_barrier(0); { const v4f l12 = GDN_L4(54, 12); const v4f l13 = GDN_L4(54, 13); __builtin_amdgcn_sched_barrier(0); x54 -= l12.x * x48; x54 -= l12.y * x49; x54 -= l12.z * x50; x54 -= l12.w * x51; x54 -= l13.x * x52; x54 -= l13.y * x53; } __builtin_amdgcn_sched_barrier(0);
        float x55 = GDN_RHS(55); { const v4f l0 = GDN_L4(55, 0); const v4f l1 = GDN_L4(55, 1); const v4f l2 = GDN_L4(55, 2); const v4f l3 = GDN_L4(55, 3); const v4f l4 = GDN_L4(55, 4); const v4f l5 = GDN_L4(55, 5); __builtin_amdgcn_sched_barrier(0); x55 -= l0.x * x0; x55 -= l0.y * x1; x55 -= l0.z * x2; x55 -= l0.w * x3; x55 -= l1.x * x4; x55 -= l1.y * x5; x55 -= l1.z * x6; x55 -= l1.w * x7; x55 -= l2.x * x8; x55 -= l2.y * x9; x55 -= l2.z * x10; x55 -= l2.w * x11; x55 -= l3.x * x12; x55 -= l3.y * x13; x55 -= l3.z * x14; x55 -= l3.w * x15; x55 -= l4.x * x16; x55 -= l4.y * x17; x55 -= l4.z * x18; x55 -= l4.w * x19; x55 -= l5.x * x20; x55 -= l5.y * x21; x55 -= l5.z * x22; x55 -= l5.w * x23; } __builtin_amdgcn_sched_barrier(0); { const v4f l6 = GDN_L4(55, 6); const v4f l7 = GDN_L4(55, 7); const v4f l8 = GDN_L4(55, 8); const v4f l9 = GDN_L4(55, 9); const v4f l10 = GDN_L4(55, 10); const v4f l11 = GDN_L4(55, 11); __builtin_amdgcn_sched_barrier(0); x55 -= l6.x * x24; x55 -= l6.y * x25; x55 -= l6.z * x26; x55 -= l6.w * x27; x55 -= l7.x * x28; x55 -= l7.y * x29; x55 -= l7.z * x30; x55 -= l7.w * x31; x55 -= l8.x * x32; x55 -= l8.y * x33; x55 -= l8.z * x34; x55 -= l8.w * x35; x55 -= l9.x * x36; x55 -= l9.y * x37; x55 -= l9.z * x38; x55 -= l9.w * x39; x55 -= l10.x * x40; x55 -= l10.y * x41; x55 -= l10.z * x42; x55 -= l10.w * x43; x55 -= l11.x * x44; x55 -= l11.y * x45; x55 -= l11.z * x46; x55 -= l11.w * x47; } __builtin_amdgcn_sched_barrier(0); { const v4f l12 = GDN_L4(55, 12); const v4f l13 = GDN_L4(55, 13); __builtin_amdgcn_sched_barrier(0); x55 -= l12.x * x48; x55 -= l12.y * x49; x55 -= l12.z * x50; x55 -= l12.w * x51; x55 -= l13.x * x52; x55 -= l13.y * x53; x55 -= l13.z * x54; } __builtin_amdgcn_sched_barrier(0);
        float x56 = GDN_RHS(56); { const v4f l0 = GDN_L4(56, 0); const v4f l1 = GDN_L4(56, 1); const v4f l2 = GDN_L4(56, 2); const v4f l3 = GDN_L4(56, 3); const v4f l4 = GDN_L4(56, 4); const v4f l5 = GDN_L4(56, 5); __builtin_amdgcn_sched_barrier(0); x56 -= l0.x * x0; x56 -= l0.y * x1; x56 -= l0.z * x2; x56 -= l0.w * x3; x56 -= l1.x * x4; x56 -= l1.y * x5; x56 -= l1.z * x6; x56 -= l1.w * x7; x56 -= l2.x * x8; x56 -= l2.y * x9; x56 -= l2.z * x10; x56 -= l2.w * x11; x56 -= l3.x * x12; x56 -= l3.y * x13; x56 -= l3.z * x14; x56 -= l3.w * x15; x56 -= l4.x * x16; x56 -= l4.y * x17; x56 -= l4.z * x18; x56 -= l4.w * x19; x56 -= l5.x * x20; x56 -= l5.y * x21; x56 -= l5.z * x22; x56 -= l5.w * x23; } __builtin_amdgcn_sched_barrier(0); { const v4f l6 = GDN_L4(56, 6); const v4f l7 = GDN_L4(56, 7); const v4f l8 = GDN_L4(56, 8); const v4f l9 = GDN_L4(56, 9); const v4f l10 = GDN_L4(56, 10); const v4f l11 = GDN_L4(56, 11); __builtin_amdgcn_sched_barrier(0); x56 -= l6.x * x24; x56 -= l6.y * x25; x56 -= l6.z * x26; x56 -= l6.w * x27; x56 -= l7.x * x28; x56 -= l7.y * x29; x56 -= l7.z * x30; x56 -= l7.w * x31; x56 -= l8.x * x32; x56 -= l8.y * x33; x56 -= l8.z * x34; x56 -= l8.w * x35; x56 -= l9.x * x36; x56 -= l9.y * x37; x56 -= l9.z * x38; x56 -= l9.w * x39; x56 -= l10.x * x40; x56 -= l10.y * x41; x56 -= l10.z * x42; x56 -= l10.w * x43; x56 -= l11.x * x44; x56 -= l11.y * x45; x56 -= l11.z * x46; x56 -= l11.w * x47; } __builtin_amdgcn_sched_barrier(0); { const v4f l12 = GDN_L4(56, 12); const v4f l13 = GDN_L4(56, 13); __builtin_amdgcn_sched_barrier(0); x56 -= l12.x * x48; x56 -= l12.y * x49; x56 -= l12.z * x50; x56 -= l12.w * x51; x56 -= l13.x * x52; x56 -= l13.y * x53; x56 -= l13.z * x54; x56 -= l13.w * x55; } __builtin_amdgcn_sched_barrier(0);
        float x57 = GDN_RHS(57); { const v4f l0 = GDN_L4(57, 0); const v4f l1 = GDN_L4(57, 1); const v4f l2 = GDN_L4(57, 2); const v4f l3 = GDN_L4(57, 3); const v4f l4 = GDN_L4(57, 4); const v4f l5 = GDN_L4(57, 5); __builtin_amdgcn_sched_barrier(0); x57 -= l0.x * x0; x57 -= l0.y * x1; x57 -= l0.z * x2; x57 -= l0.w * x3; x57 -= l1.x * x4; x57 -= l1.y * x5; x57 -= l1.z * x6; x57 -= l1.w * x7; x57 -= l2.x * x8; x57 -= l2.y * x9; x57 -= l2.z * x10; x57 -= l2.w * x11; x57 -= l3.x * x12; x57 -= l3.y * x13; x57 -= l3.z * x14; x57 -= l3.w * x15; x57 -= l4.x * x16; x57 -= l4.y * x17; x57 -= l4.z * x18; x57 -= l4.w * x19; x57 -= l5.x * x20; x57 -= l5.y * x21; x57 -= l5.z * x22; x57 -= l5.w * x23; } __builtin_amdgcn_sched_barrier(0); { const v4f l6 = GDN_L4(57, 6); const v4f l7 = GDN_L4(57, 7); const v4f l8 = GDN_L4(57, 8); const v4f l9 = GDN_L4(57, 9); const v4f l10 = GDN_L4(57, 10); const v4f l11 = GDN_L4(57, 11); __builtin_amdgcn_sched_barrier(0); x57 -= l6.x * x24; x57 -= l6.y * x25; x57 -= l6.z * x26; x57 -= l6.w * x27; x57 -= l7.x * x28; x57 -= l7.y * x29; x57 -= l7.z * x30; x57 -= l7.w * x31; x57 -= l8.x * x32; x57 -= l8.y * x33; x57 -= l8.z * x34; x57 -= l8.w * x35; x57 -= l9.x * x36; x57 -= l9.y * x37; x57 -= l9.z * x38; x57 -= l9.w * x39; x57 -= l10.x * x40; x57 -= l10.y * x41; x57 -= l10.z * x42; x57 -= l10.w * x43; x57 -= l11.x * x44; x57 -= l11.y * x45; x57 -= l11.z * x46; x57 -= l11.w * x47; } __builtin_amdgcn_sched_barrier(0); { const v4f l12 = GDN_L4(57, 12); const v4f l13 = GDN_L4(57, 13); const v4f l14 = GDN_L4(57, 14); __builtin_amdgcn_sched_barrier(0); x57 -= l12.x * x48; x57 -= l12.y * x49; x57 -= l12.z * x50; x57 -= l12.w * x51; x57 -= l13.x * x52; x57 -= l13.y * x53; x57 -= l13.z * x54; x57 -= l13.w * x55; x57 -= l14.x * x56; } __builtin_amdgcn_sched_barrier(0);
        float x58 = GDN_RHS(58); { const v4f l0 = GDN_L4(58, 0); const v4f l1 = GDN_L4(58, 1); const v4f l2 = GDN_L4(58, 2); const v4f l3 = GDN_L4(58, 3); const v4f l4 = GDN_L4(58, 4); const v4f l5 = GDN_L4(58, 5); __builtin_amdgcn_sched_barrier(0); x58 -= l0.x * x0; x58 -= l0.y * x1; x58 -= l0.z * x2; x58 -= l0.w * x3; x58 -= l1.x * x4; x58 -= l1.y * x5; x58 -= l1.z * x6; x58 -= l1.w * x7; x58 -= l2.x * x8; x58 -= l2.y * x9; x58 -= l2.z * x10; x58 -= l2.w * x11; x58 -= l3.x * x12; x58 -= l3.y * x13; x58 -= l3.z * x14; x58 -= l3.w * x15; x58 -= l4.x * x16; x58 -= l4.y * x17; x58 -= l4.z * x18; x58 -= l4.w * x19; x58 -= l5.x * x20; x58 -= l5.y * x21; x58 -= l5.z * x22; x58 -= l5.w * x23; } __builtin_amdgcn_sched_barrier(0); { const v4f l6 = GDN_L4(58, 6); const v4f l7 = GDN_L4(58, 7); const v4f l8 = GDN_L4(58, 8); const v4f l9 = GDN_L4(58, 9); const v4f l10 = GDN_L4(58, 10); const v4f l11 = GDN_L4(58, 11); __builtin_amdgcn_sched_barrier(0); x58 -= l6.x * x24; x58 -= l6.y * x25; x58 -= l6.z * x26; x58 -= l6.w * x27; x58 -= l7.x * x28; x58 -= l7.y * x29; x58 -= l7.z * x30; x58 -= l7.w * x31; x58 -= l8.x * x32; x58 -= l8.y * x33; x58 -= l8.z * x34; x58 -= l8.w * x35; x58 -= l9.x * x36; x58 -= l9.y * x37; x58 -= l9.z * x38; x58 -= l9.w * x39; x58 -= l10.x * x40; x58 -= l10.y * x41; x58 -= l10.z * x42; x58 -= l10.w * x43; x58 -= l11.x * x44; x58 -= l11.y * x45; x58 -= l11.z * x46; x58 -= l11.w * x47; } __builtin_amdgcn_sched_barrier(0); { const v4f l12 = GDN_L4(58, 12); const v4f l13 = GDN_L4(58, 13); const v4f l14 = GDN_L4(58, 14); __builtin_amdgcn_sched_barrier(0); x58 -= l12.x * x48; x58 -= l12.y * x49; x58 -= l12.z * x50; x58 -= l12.w * x51; x58 -= l13.x * x52; x58 -= l13.y * x53; x58 -= l13.z * x54; x58 -= l13.w * x55; x58 -= l14.x * x56; x58 -= l14.y * x57; } __builtin_amdgcn_sched_barrier(0);
        float x59 = GDN_RHS(59); { const v4f l0 = GDN_L4(59, 0); const v4f l1 = GDN_L4(59, 1); const v4f l2 = GDN_L4(59, 2); const v4f l3 = GDN_L4(59, 3); const v4f l4 = GDN_L4(59, 4); const v4f l5 = GDN_L4(59, 5); __builtin_amdgcn_sched_barrier(0); x59 -= l0.x * x0; x59 -= l0.y * x1; x59 -= l0.z * x2; x59 -= l0.w * x3; x59 -= l1.x * x4; x59 -= l1.y * x5; x59 -= l1.z * x6; x59 -= l1.w * x7; x59 -= l2.x * x8; x59 -= l2.y * x9; x59 -= l2.z * x10; x59 -= l2.w * x11; x59 -= l3.x * x12; x59 -= l3.y * x13; x59 -= l3.z * x14; x59 -= l3.w * x15; x59 -= l4.x * x16; x59 -= l4.y * x17; x59 -= l4.z * x18; x59 -= l4.w * x19; x59 -= l5.x * x20; x59 -= l5.y * x21; x59 -= l5.z * x22; x59 -= l5.w * x23; } __builtin_amdgcn_sched_barrier(0); { const v4f l6 = GDN_L4(59, 6); const v4f l7 = GDN_L4(59, 7); const v4f l8 = GDN_L4(59, 8); const v4f l9 = GDN_L4(59, 9); const v4f l10 = GDN_L4(59, 10); const v4f l11 = GDN_L4(59, 11); __builtin_amdgcn_sched_barrier(0); x59 -= l6.x * x24; x59 -= l6.y * x25; x59 -= l6.z * x26; x59 -= l6.w * x27; x59 -= l7.x * x28; x59 -= l7.y * x29; x59 -= l7.z * x30; x59 -= l7.w * x31; x59 -= l8.x * x32; x59 -= l8.y * x33; x59 -= l8.z * x34; x59 -= l8.w * x35; x59 -= l9.x * x36; x59 -= l9.y * x37; x59 -= l9.z * x38; x59 -= l9.w * x39; x59 -= l10.x * x40; x59 -= l10.y * x41; x59 -= l10.z * x42; x59 -= l10.w * x43; x59 -= l11.x * x44; x59 -= l11.y * x45; x59 -= l11.z * x46; x59 -= l11.w * x47; } __builtin_amdgcn_sched_barrier(0); { const v4f l12 = GDN_L4(59, 12); const v4f l13 = GDN_L4(59, 13); const v4f l14 = GDN_L4(59, 14); __builtin_amdgcn_sched_barrier(0); x59 -= l12.x * x48; x59 -= l12.y * x49; x59 -= l12.z * x50; x59 -= l12.w * x51; x59 -= l13.x * x52; x59 -= l13.y * x53; x59 -= l13.z * x54; x59 -= l13.w * x55; x59 -= l14.x * x56; x59 -= l14.y * x57; x59 -= l14.z * x58; } __builtin_amdgcn_sched_barrier(0);
        float x60 = GDN_RHS(60); { const v4f l0 = GDN_L4(60, 0); const v4f l1 = GDN_L4(60, 1); const v4f l2 = GDN_L4(60, 2); const v4f l3 = GDN_L4(60, 3); const v4f l4 = GDN_L4(60, 4); const v4f l5 = GDN_L4(60, 5); __builtin_amdgcn_sched_barrier(0); x60 -= l0.x * x0; x60 -= l0.y * x1; x60 -= l0.z * x2; x60 -= l0.w * x3; x60 -= l1.x * x4; x60 -= l1.y * x5; x60 -= l1.z * x6; x60 -= l1.w * x7; x60 -= l2.x * x8; x60 -= l2.y * x9; x60 -= l2.z * x10; x60 -= l2.w * x11; x60 -= l3.x * x12; x60 -= l3.y * x13; x60 -= l3.z * x14; x60 -= l3.w * x15; x60 -= l4.x * x16; x60 -= l4.y * x17; x60 -= l4.z * x18; x60 -= l4.w * x19; x60 -= l5.x * x20; x60 -= l5.y * x21; x60 -= l5.z * x22; x60 -= l5.w * x23; } __builtin_amdgcn_sched_barrier(0); { const v4f l6 = GDN_L4(60, 6); const v4f l7 = GDN_L4(60, 7); const v4f l8 = GDN_L4(60, 8); const v4f l9 = GDN_L4(60, 9); const v4f l10 = GDN_L4(60, 10); const v4f l11 = GDN_L4(60, 11); __builtin_amdgcn_sched_barrier(0); x60 -= l6.x * x24; x60 -= l6.y * x25; x60 -= l6.z * x26; x60 -= l6.w * x27; x60 -= l7.x * x28; x60 -= l7.y * x29; x60 -= l7.z * x30; x60 -= l7.w * x31; x60 -= l8.x * x32; x60 -= l8.y * x33; x60 -= l8.z * x34; x60 -= l8.w * x35; x60 -= l9.x * x36; x60 -= l9.y * x37; x60 -= l9.z * x38; x60 -= l9.w * x39; x60 -= l10.x * x40; x60 -= l10.y * x41; x60 -= l10.z * x42; x60 -= l10.w * x43; x60 -= l11.x * x44; x60 -= l11.y * x45; x60 -= l11.z * x46; x60 -= l11.w * x47; } __builtin_amdgcn_sched_barrier(0); { const v4f l12 = GDN_L4(60, 12); const v4f l13 = GDN_L4(60, 13); const v4f l14 = GDN_L4(60, 14); __builtin_amdgcn_sched_barrier(0); x60 -= l12.x * x48; x60 -= l12.y * x49; x60 -= l12.z * x50; x60 -= l12.w * x51; x60 -= l13.x * x52; x60 -= l13.y * x53; x60 -= l13.z * x54; x60 -= l13.w * x55; x60 -= l14.x * x56; x60 -= l14.y * x57; x60 -= l14.z * x58; x60 -= l14.w * x59; } __builtin_amdgcn_sched_barrier(0);
        float x61 = GDN_RHS(61); { const v4f l0 = GDN_L4(61, 0); const v4f l1 = GDN_L4(61, 1); const v4f l2 = GDN_L4(61, 2); const v4f l3 = GDN_L4(61, 3); const v4f l4 = GDN_L4(61, 4); const v4f l5 = GDN_L4(61, 5); __builtin_amdgcn_sched_barrier(0); x61 -= l0.x * x0; x61 -= l0.y * x1; x61 -= l0.z * x2; x61 -= l0.w * x3; x61 -= l1.x * x4; x61 -= l1.y * x5; x61 -= l1.z * x6; x61 -= l1.w * x7; x61 -= l2.x * x8; x61 -= l2.y * x9; x61 -= l2.z * x10; x61 -= l2.w * x11; x61 -= l3.x * x12; x61 -= l3.y * x13; x61 -= l3.z * x14; x61 -= l3.w * x15; x61 -= l4.x * x16; x61 -= l4.y * x17; x61 -= l4.z * x18; x61 -= l4.w * x19; x61 -= l5.x * x20; x61 -= l5.y * x21; x61 -= l5.z * x22; x61 -= l5.w * x23; } __builtin_amdgcn_sched_barrier(0); { const v4f l6 = GDN_L4(61, 6); const v4f l7 = GDN_L4(61, 7); const v4f l8 = GDN_L4(61, 8); const v4f l9 = GDN_L4(61, 9); const v4f l10 = GDN_L4(61, 10); const v4f l11 = GDN_L4(61, 11); __builtin_amdgcn_sched_barrier(0); x61 -= l6.x * x24; x61 -= l6.y * x25; x61 -= l6.z * x26; x61 -= l6.w * x27; x61 -= l7.x * x28; x61 -= l7.y * x29; x61 -= l7.z * x30; x61 -= l7.w * x31; x61 -= l8.x * x32; x61 -= l8.y * x33; x61 -= l8.z * x34; x61 -= l8.w * x35; x61 -= l9.x * x36; x61 -= l9.y * x37; x61 -= l9.z * x38; x61 -= l9.w * x39; x61 -= l10.x * x40; x61 -= l10.y * x41; x61 -= l10.z * x42; x61 -= l10.w * x43; x61 -= l11.x * x44; x61 -= l11.y * x45; x61 -= l11.z * x46; x61 -= l11.w * x47; } __builtin_amdgcn_sched_barrier(0); { const v4f l12 = GDN_L4(61, 12); const v4f l13 = GDN_L4(61, 13); const v4f l14 = GDN_L4(61, 14); const v4f l15 = GDN_L4(61, 15); __builtin_amdgcn_sched_barrier(0); x61 -= l12.x * x48; x61 -= l12.y * x49; x61 -= l12.z * x50; x61 -= l12.w * x51; x61 -= l13.x * x52; x61 -= l13.y * x53; x61 -= l13.z * x54; x61 -= l13.w * x55; x61 -= l14.x * x56; x61 -= l14.y * x57; x61 -= l14.z * x58; x61 -= l14.w * x59; x61 -= l15.x * x60; } __builtin_amdgcn_sched_barrier(0);
        float x62 = GDN_RHS(62); { const v4f l0 = GDN_L4(62, 0); const v4f l1 = GDN_L4(62, 1); const v4f l2 = GDN_L4(62, 2); const v4f l3 = GDN_L4(62, 3); const v4f l4 = GDN_L4(62, 4); const v4f l5 = GDN_L4(62, 5); __builtin_amdgcn_sched_barrier(0); x62 -= l0.x * x0; x62 -= l0.y * x1; x62 -= l0.z * x2; x62 -= l0.w * x3; x62 -= l1.x * x4; x62 -= l1.y * x5; x62 -= l1.z * x6; x62 -= l1.w * x7; x62 -= l2.x * x8; x62 -= l2.y * x9; x62 -= l2.z * x10; x62 -= l2.w * x11; x62 -= l3.x * x12; x62 -= l3.y * x13; x62 -= l3.z * x14; x62 -= l3.w * x15; x62 -= l4.x * x16; x62 -= l4.y * x17; x62 -= l4.z * x18; x62 -= l4.w * x19; x62 -= l5.x * x20; x62 -= l5.y * x21; x62 -= l5.z * x22; x62 -= l5.w * x23; } __builtin_amdgcn_sched_barrier(0); { const v4f l6 = GDN_L4(62, 6); const v4f l7 = GDN_L4(62, 7); const v4f l8 = GDN_L4(62, 8); const v4f l9 = GDN_L4(62, 9); const v4f l10 = GDN_L4(62, 10); const v4f l11 = GDN_L4(62, 11); __builtin_amdgcn_sched_barrier(0); x62 -= l6.x * x24; x62 -= l6.y * x25; x62 -= l6.z * x26; x62 -= l6.w * x27; x62 -= l7.x * x28; x62 -= l7.y * x29; x62 -= l7.z * x30; x62 -= l7.w * x31; x62 -= l8.x * x32; x62 -= l8.y * x33; x62 -= l8.z * x34; x62 -= l8.w * x35; x62 -= l9.x * x36; x62 -= l9.y * x37; x62 -= l9.z * x38; x62 -= l9.w * x39; x62 -= l10.x * x40; x62 -= l10.y * x41; x62 -= l10.z * x42; x62 -= l10.w * x43; x62 -= l11.x * x44; x62 -= l11.y * x45; x62 -= l11.z * x46; x62 -= l11.w * x47; } __builtin_amdgcn_sched_barrier(0); { const v4f l12 = GDN_L4(62, 12); const v4f l13 = GDN_L4(62, 13); const v4f l14 = GDN_L4(62, 14); const v4f l15 = GDN_L4(62, 15); __builtin_amdgcn_sched_barrier(0); x62 -= l12.x * x48; x62 -= l12.y * x49; x62 -= l12.z * x50; x62 -= l12.w * x51; x62 -= l13.x * x52; x62 -= l13.y * x53; x62 -= l13.z * x54; x62 -= l13.w * x55; x62 -= l14.x * x56; x62 -= l14.y * x57; x62 -= l14.z * x58; x62 -= l14.w * x59; x62 -= l15.x * x60; x62 -= l15.y * x61; } __builtin_amdgcn_sched_barrier(0);
        float x63 = GDN_RHS(63); { const v4f l0 = GDN_L4(63, 0); const v4f l1 = GDN_L4(63, 1); const v4f l2 = GDN_L4(63, 2); const v4f l3 = GDN_L4(63, 3); const v4f l4 = GDN_L4(63, 4); const v4f l5 = GDN_L4(63, 5); __builtin_amdgcn_sched_barrier(0); x63 -= l0.x * x0; x63 -= l0.y * x1; x63 -= l0.z * x2; x63 -= l0.w * x3; x63 -= l1.x * x4; x63 -= l1.y * x5; x63 -= l1.z * x6; x63 -= l1.w * x7; x63 -= l2.x * x8; x63 -= l2.y * x9; x63 -= l2.z * x10; x63 -= l2.w * x11; x63 -= l3.x * x12; x63 -= l3.y * x13; x63 -= l3.z * x14; x63 -= l3.w * x15; x63 -= l4.x * x16; x63 -= l4.y * x17; x63 -= l4.z * x18; x63 -= l4.w * x19; x63 -= l5.x * x20; x63 -= l5.y * x21; x63 -= l5.z * x22; x63 -= l5.w * x23; } __builtin_amdgcn_sched_barrier(0); { const v4f l6 = GDN_L4(63, 6); const v4f l7 = GDN_L4(63, 7); const v4f l8 = GDN_L4(63, 8); const v4f l9 = GDN_L4(63, 9); const v4f l10 = GDN_L4(63, 10); const v4f l11 = GDN_L4(63, 11); __builtin_amdgcn_sched_barrier(0); x63 -= l6.x * x24; x63 -= l6.y * x25; x63 -= l6.z * x26; x63 -= l6.w * x27; x63 -= l7.x * x28; x63 -= l7.y * x29; x63 -= l7.z * x30; x63 -= l7.w * x31; x63 -= l8.x * x32; x63 -= l8.y * x33; x63 -= l8.z * x34; x63 -= l8.w * x35; x63 -= l9.x * x36; x63 -= l9.y * x37; x63 -= l9.z * x38; x63 -= l9.w * x39; x63 -= l10.x * x40; x63 -= l10.y * x41; x63 -= l10.z * x42; x63 -= l10.w * x43; x63 -= l11.x * x44; x63 -= l11.y * x45; x63 -= l11.z * x46; x63 -= l11.w * x47; } __builtin_amdgcn_sched_barrier(0); { const v4f l12 = GDN_L4(63, 12); const v4f l13 = GDN_L4(63, 13); const v4f l14 = GDN_L4(63, 14); const v4f l15 = GDN_L4(63, 15); __builtin_amdgcn_sched_barrier(0); x63 -= l12.x * x48; x63 -= l12.y * x49; x63 -= l12.z * x50; x63 -= l12.w * x51; x63 -= l13.x * x52; x63 -= l13.y * x53; x63 -= l13.z * x54; x63 -= l13.w * x55; x63 -= l14.x * x56; x63 -= l14.y * x57; x63 -= l14.z * x58; x63 -= l14.w * x59; x63 -= l15.x * x60; x63 -= l15.y * x61; x63 -= l15.z * x62; } __builtin_amdgcn_sched_barrier(0);
        if (c < 128) { GU[0 * 128 + c] = x0; GU[1 * 128 + c] = x1; GU[2 * 128 + c] = x2; GU[3 * 128 + c] = x3; GU[4 * 128 + c] = x4; GU[5 * 128 + c] = x5; GU[6 * 128 + c] = x6; GU[7 * 128 + c] = x7; GU[8 * 128 + c] = x8; GU[9 * 128 + c] = x9; GU[10 * 128 + c] = x10; GU[11 * 128 + c] = x11; GU[12 * 128 + c] = x12; GU[13 * 128 + c] = x13; GU[14 * 128 + c] = x14; GU[15 * 128 + c] = x15; GU[16 * 128 + c] = x16; GU[17 * 128 + c] = x17; GU[18 * 128 + c] = x18; GU[19 * 128 + c] = x19; GU[20 * 128 + c] = x20; GU[21 * 128 + c] = x21; GU[22 * 128 + c] = x22; GU[23 * 128 + c] = x23; GU[24 * 128 + c] = x24; GU[25 * 128 + c] = x25; GU[26 * 128 + c] = x26; GU[27 * 128 + c] = x27; GU[28 * 128 + c] = x28; GU[29 * 128 + c] = x29; GU[30 * 128 + c] = x30; GU[31 * 128 + c] = x31; GU[32 * 128 + c] = x32; GU[33 * 128 + c] = x33; GU[34 * 128 + c] = x34; GU[35 * 128 + c] = x35; GU[36 * 128 + c] = x36; GU[37 * 128 + c] = x37; GU[38 * 128 + c] = x38; GU[39 * 128 + c] = x39; GU[40 * 128 + c] = x40; GU[41 * 128 + c] = x41; GU[42 * 128 + c] = x42; GU[43 * 128 + c] = x43; GU[44 * 128 + c] = x44; GU[45 * 128 + c] = x45; GU[46 * 128 + c] = x46; GU[47 * 128 + c] = x47; GU[48 * 128 + c] = x48; GU[49 * 128 + c] = x49; GU[50 * 128 + c] = x50; GU[51 * 128 + c] = x51; GU[52 * 128 + c] = x52; GU[53 * 128 + c] = x53; GU[54 * 128 + c] = x54; GU[55 * 128 + c] = x55; GU[56 * 128 + c] = x56; GU[57 * 128 + c] = x57; GU[58 * 128 + c] = x58; GU[59 * 128 + c] = x59; GU[60 * 128 + c] = x60; GU[61 * 128 + c] = x61; GU[62 * 128 + c] = x62; GU[63 * 128 + c] = x63; }
        else { GNW[0 * 128 + (c - 128)] = (bf16)f2bf(-x0); GNW[1 * 128 + (c - 128)] = (bf16)f2bf(-x1); GNW[2 * 128 + (c - 128)] = (bf16)f2bf(-x2); GNW[3 * 128 + (c - 128)] = (bf16)f2bf(-x3); GNW[4 * 128 + (c - 128)] = (bf16)f2bf(-x4); GNW[5 * 128 + (c - 128)] = (bf16)f2bf(-x5); GNW[6 * 128 + (c - 128)] = (bf16)f2bf(-x6); GNW[7 * 128 + (c - 128)] = (bf16)f2bf(-x7); GNW[8 * 128 + (c - 128)] = (bf16)f2bf(-x8); GNW[9 * 128 + (c - 128)] = (bf16)f2bf(-x9); GNW[10 * 128 + (c - 128)] = (bf16)f2bf(-x10); GNW[11 * 128 + (c - 128)] = (bf16)f2bf(-x11); GNW[12 * 128 + (c - 128)] = (bf16)f2bf(-x12); GNW[13 * 128 + (c - 128)] = (bf16)f2bf(-x13); GNW[14 * 128 + (c - 128)] = (bf16)f2bf(-x14); GNW[15 * 128 + (c - 128)] = (bf16)f2bf(-x15); GNW[16 * 128 + (c - 128)] = (bf16)f2bf(-x16); GNW[17 * 128 + (c - 128)] = (bf16)f2bf(-x17); GNW[18 * 128 + (c - 128)] = (bf16)f2bf(-x18); GNW[19 * 128 + (c - 128)] = (bf16)f2bf(-x19); GNW[20 * 128 + (c - 128)] = (bf16)f2bf(-x20); GNW[21 * 128 + (c - 128)] = (bf16)f2bf(-x21); GNW[22 * 128 + (c - 128)] = (bf16)f2bf(-x22); GNW[23 * 128 + (c - 128)] = (bf16)f2bf(-x23); GNW[24 * 128 + (c - 128)] = (bf16)f2bf(-x24); GNW[25 * 128 + (c - 128)] = (bf16)f2bf(-x25); GNW[26 * 128 + (c - 128)] = (bf16)f2bf(-x26); GNW[27 * 128 + (c - 128)] = (bf16)f2bf(-x27); GNW[28 * 128 + (c - 128)] = (bf16)f2bf(-x28); GNW[29 * 128 + (c - 128)] = (bf16)f2bf(-x29); GNW[30 * 128 + (c - 128)] = (bf16)f2bf(-x30); GNW[31 * 128 + (c - 128)] = (bf16)f2bf(-x31); GNW[32 * 128 + (c - 128)] = (bf16)f2bf(-x32); GNW[33 * 128 + (c - 128)] = (bf16)f2bf(-x33); GNW[34 * 128 + (c - 128)] = (bf16)f2bf(-x34); GNW[35 * 128 + (c - 128)] = (bf16)f2bf(-x35); GNW[36 * 128 + (c - 128)] = (bf16)f2bf(-x36); GNW[37 * 128 + (c - 128)] = (bf16)f2bf(-x37); GNW[38 * 128 + (c - 128)] = (bf16)f2bf(-x38); GNW[39 * 128 + (c - 128)] = (bf16)f2bf(-x39); GNW[40 * 128 + (c - 128)] = (bf16)f2bf(-x40); GNW[41 * 128 + (c - 128)] = (bf16)f2bf(-x41); GNW[42 * 128 + (c - 128)] = (bf16)f2bf(-x42); GNW[43 * 128 + (c - 128)] = (bf16)f2bf(-x43); GNW[44 * 128 + (c - 128)] = (bf16)f2bf(-x44); GNW[45 * 128 + (c - 128)] = (bf16)f2bf(-x45); GNW[46 * 128 + (c - 128)] = (bf16)f2bf(-x46); GNW[47 * 128 + (c - 128)] = (bf16)f2bf(-x47); GNW[48 * 128 + (c - 128)] = (bf16)f2bf(-x48); GNW[49 * 128 + (c - 128)] = (bf16)f2bf(-x49); GNW[50 * 128 + (c - 128)] = (bf16)f2bf(-x50); GNW[51 * 128 + (c - 128)] = (bf16)f2bf(-x51); GNW[52 * 128 + (c - 128)] = (bf16)f2bf(-x52); GNW[53 * 128 + (c - 128)] = (bf16)f2bf(-x53); GNW[54 * 128 + (c - 128)] = (bf16)f2bf(-x54); GNW[55 * 128 + (c - 128)] = (bf16)f2bf(-x55); GNW[56 * 128 + (c - 128)] = (bf16)f2bf(-x56); GNW[57 * 128 + (c - 128)] = (bf16)f2bf(-x57); GNW[58 * 128 + (c - 128)] = (bf16)f2bf(-x58); GNW[59 * 128 + (c - 128)] = (bf16)f2bf(-x59); GNW[60 * 128 + (c - 128)] = (bf16)f2bf(-x60); GNW[61 * 128 + (c - 128)] = (bf16)f2bf(-x61); GNW[62 * 128 + (c - 128)] = (bf16)f2bf(-x62); GNW[63 * 128 + (c - 128)] = (bf16)f2bf(-x63); }
#undef GDN_RHS
#undef GDN_L4
    } else {
        const int t2 = tid - 256; const float gl = gcs[63];
        { const int i = t2 >> 2, d0 = (t2 & 3) * 32; const float e = __expf(gcs[i]);
#pragma unroll
          for (int x8 = 0; x8 < 4; ++x8) { const v4f a = *(const LAS v4f*)(qs + i * QP + d0 + 8 * x8), b = *(const LAS v4f*)(qs + i * QP + d0 + 8 * x8 + 4);
              v4u w; w.x = pk2(a.x * e, a.y * e); w.y = pk2(a.z * e, a.w * e); w.z = pk2(b.x * e, b.y * e); w.w = pk2(b.z * e, b.w * e); *(v4u*)(GQG + i * 128 + d0 + 8 * x8) = w; } }
        { const int d = t2 >> 1, j0 = (t2 & 1) * 32;
#pragma unroll
          for (int x8 = 0; x8 < 4; ++x8) { float o[8];
#pragma unroll
              for (int x = 0; x < 8; ++x) { const int j = j0 + 8 * x8 + x; o[x] = ks[j * QP + d] * __expf(gl - gcs[j]); }
              v4u w; w.x = pk2(o[0], o[1]); w.y = pk2(o[2], o[3]); w.z = pk2(o[4], o[5]); w.w = pk2(o[6], o[7]); *(v4u*)(GKT + d * 64 + j0 + 8 * x8) = w; } }
        if (t2 == 0) GDL[item] = __expf(gl);
    }
    __syncthreads();
}
struct GdnFrags { bf16x8_t nw[4], qg[4], at[2], kt[2][2]; float u[4]; float dl; };
__device__ __forceinline__ void gdn_load(GdnFrags& F, const Params& p, int item, int off128, int off64, int offk, int offu) {
    const bf16* GNW = (const bf16*)(p.ws + WS_GNW) + (size_t)item * 8192; const bf16* GQG = (const bf16*)(p.ws + WS_GQG) + (size_t)item * 8192;
    const bf16* GAT = (const bf16*)(p.ws + WS_GAT) + (size_t)item * 4096; const bf16* GKT = (const bf16*)(p.ws + WS_GKT) + (size_t)item * 8192; const float* GU = (const float*)(p.ws + WS_GU) + (size_t)item * 8192;
#pragma unroll
    for (int ks = 0; ks < 4; ++ks) { F.nw[ks] = *(const bf16x8_t*)(GNW + off128 + 32 * ks); F.qg[ks] = *(const bf16x8_t*)(GQG + off128 + 32 * ks); }
#pragma unroll
    for (int ks = 0; ks < 2; ++ks) { F.at[ks] = *(const bf16x8_t*)(GAT + off64 + 32 * ks); F.kt[0][ks] = *(const bf16x8_t*)(GKT + offk + 32 * ks); F.kt[1][ks] = *(const bf16x8_t*)(GKT + offk + 1024 + 32 * ks); }
#pragma unroll
    for (int r = 0; r < 4; ++r) F.u[r] = GU[offu + r * 128];
    F.dl = ((const float*)(p.ws + WS_GDL))[item];
}
constexpr int STP = 136, VNP = 72;
__device__ __forceinline__ void gdn_seq(const Params& p, LAS unsigned char* lds, int wgi, int wave, int lane) {
    const int u = wgi * 2 + (wave >> 2), wi = wave & 3, h = u >> 3, sl = u & 7, g = lane >> 4, c = lane & 15;
    LAS unsigned short* ST = (LAS unsigned short*)(lds + (wave >> 2) * 12288);
    LAS unsigned short* VNT = ST + 2 * 16 * STP;
    float* GO = (float*)(p.ws + WS_GO);
    const int off128 = (16 * wi + c) * 128 + 8 * g, off64 = (16 * wi + c) * 64 + 8 * g, offk = (32 * wi + c) * 64 + 8 * g, offu = (16 * wi + 4 * g) * 128 + 16 * sl + c;
#pragma unroll
    for (int mt = 0; mt < 2; ++mt) *(LAS v2u*)(ST + c * STP + 16 * (2 * wi + mt) + 4 * g) = (v2u){0u, 0u};
    pg8::f32x4 Sacc[2] = {{0.f, 0.f, 0.f, 0.f}, {0.f, 0.f, 0.f, 0.f}};
    __syncthreads();
    GdnFrags F0, F1;
    gdn_load(F0, p, h, off128, off64, offk, offu);
#define GDN_STEP(F, n_) do { const int cur = (n_) & 1; bf16x8_t sf[4]; \
        _Pragma("unroll") for (int ks = 0; ks < 4; ++ks) sf[ks] = *(const LAS bf16x8_t*)(ST + cur * 16 * STP + c * STP + 32 * ks + 8 * g); \
        pg8::f32x4 vn = {F.u[0], F.u[1], F.u[2], F.u[3]}; \
        _Pragma("unroll") for (int ks = 0; ks < 4; ++ks) vn = __builtin_amdgcn_mfma_f32_16x16x32_bf16(F.nw[ks], sf[ks], vn, 0, 0, 0); \
        { v2u w; w.x = pk2(vn[0], vn[1]); w.y = pk2(vn[2], vn[3]); *(LAS v2u*)(VNT + c * VNP + 16 * wi + 4 * g) = w; } \
        LDS_BAR(); \
        const bf16x8_t v0 = *(const LAS bf16x8_t*)(VNT + c * VNP + 8 * g), v1 = *(const LAS bf16x8_t*)(VNT + c * VNP + 32 + 8 * g); \
        pg8::f32x4 o = {0.f, 0.f, 0.f, 0.f}; \
        _Pragma("unroll") for (int ks = 0; ks < 4; ++ks) o = __builtin_amdgcn_mfma_f32_16x16x32_bf16(F.qg[ks], sf[ks], o, 0, 0, 0); \
        o = __builtin_amdgcn_mfma_f32_16x16x32_bf16(F.at[0], v0, o, 0, 0, 0); o = __builtin_amdgcn_mfma_f32_16x16x32_bf16(F.at[1], v1, o, 0, 0, 0); \
        { const size_t tb = (size_t)(n_) * 64 + 16 * wi + 4 * g; _Pragma("unroll") for (int r = 0; r < 4; ++r) GO[(tb + r) * BW + h * 128 + 16 * sl + c] = o[r]; } \
        _Pragma("unroll") for (int mt = 0; mt < 2; ++mt) { Sacc[mt] = Sacc[mt] * F.dl; \
            Sacc[mt] = __builtin_amdgcn_mfma_f32_16x16x32_bf16(F.kt[mt][0], v0, Sacc[mt], 0, 0, 0); Sacc[mt] = __builtin_amdgcn_mfma_f32_16x16x32_bf16(F.kt[mt][1], v1, Sacc[mt], 0, 0, 0); \
            v2u w; w.x = pk2(Sacc[mt][0], Sacc[mt][1]); w.y = pk2(Sacc[mt][2], Sacc[mt][3]); *(LAS v2u*)(ST + (cur ^ 1) * 16 * STP + c * STP + 16 * (2 * wi + mt) + 4 * g) = w; } \
        LDS_BAR(); } while (0)
    for (int n = 0; n < T / 64; n += 2) {
        gdn_load(F1, p, (n + 1) * 4 + h, off128, off64, offk, offu);
        GDN_STEP(F0, n);
        gdn_load(F0, p, ((n + 2 < T / 64) ? n + 2 : n) * 4 + h, off128, off64, offk, offu);
        GDN_STEP(F1, n + 1);
    }
#undef GDN_STEP
}

constexpr int SEQ_UOFF = 132096;
constexpr int GI_NW = 0, GI_QG = 8704, GI_AT = 17408, GI_KT = 22016, GI_SZ = 31232;
struct GdnStage { v4u r[7]; float u[4]; float dl; };
__device__ __forceinline__ void gdn_stage_load(GdnStage& Sg, const Params& p, int item, int tid, int offu) {
    const bf16* GNW = (const bf16*)(p.ws + WS_GNW) + (size_t)item * 8192; const bf16* GQG = (const bf16*)(p.ws + WS_GQG) + (size_t)item * 8192;
    const bf16* GAT = (const bf16*)(p.ws + WS_GAT) + (size_t)item * 4096; const bf16* GKT = (const bf16*)(p.ws + WS_GKT) + (size_t)item * 8192; const float* GU = (const float*)(p.ws + WS_GU) + (size_t)item * 8192;
    Sg.r[0] = *(const v4u*)(GNW + 8 * tid); Sg.r[1] = *(const v4u*)(GNW + 8 * (tid + 512)); Sg.r[2] = *(const v4u*)(GQG + 8 * tid); Sg.r[3] = *(const v4u*)(GQG + 8 * (tid + 512));
    Sg.r[4] = *(const v4u*)(GAT + 8 * tid); Sg.r[5] = *(const v4u*)(GKT + 8 * tid); Sg.r[6] = *(const v4u*)(GKT + 8 * (tid + 512));
#pragma unroll
    for (int r = 0; r < 4; ++r) Sg.u[r] = GU[offu + r * 128];
    Sg.dl = ((const float*)(p.ws + WS_GDL))[item];
}
__device__ __forceinline__ void gdn_stage_write(const GdnStage& Sg, LAS unsigned short* img, int tid) {
    { const int p0 = tid, p1 = tid + 512;
      *(LAS v4u*)(img + GI_NW + (p0 >> 4) * 136 + 8 * (p0 & 15)) = Sg.r[0]; *(LAS v4u*)(img + GI_NW + (p1 >> 4) * 136 + 8 * (p1 & 15)) = Sg.r[1];
      *(LAS v4u*)(img + GI_QG + (p0 >> 4) * 136 + 8 * (p0 & 15)) = Sg.r[2]; *(LAS v4u*)(img + GI_QG + (p1 >> 4) * 136 + 8 * (p1 & 15)) = Sg.r[3];
      *(LAS v4u*)(img + GI_AT + (p0 >> 3) * 72 + 8 * (p0 & 7)) = Sg.r[4];
      *(LAS v4u*)(img + GI_KT + (p0 >> 3) * 72 + 8 * (p0 & 7)) = Sg.r[5]; *(LAS v4u*)(img + GI_KT + (p1 >> 3) * 72 + 8 * (p1 & 7)) = Sg.r[6]; }
}
__device__ __forceinline__ void gdn_seq2(const Params& p, LAS unsigned char* lds, int wgi, int tid, int wave, int lane) {
    const int h = wgi >> 2, sl = 2 * (wgi & 3) + (wave >> 2), wi = wave & 3, g = lane >> 4, c = lane & 15;
    LAS unsigned short* IMG = (LAS unsigned short*)lds;
    LAS unsigned short* ST = (LAS unsigned short*)(lds + SEQ_UOFF + (wave >> 2) * 12288);
    LAS unsigned short* VNT = ST + 2 * 16 * STP;
    float* GO = (float*)(p.ws + WS_GO);
    const int offu = (16 * wi + 4 * g) * 128 + 16 * sl + c;
#pragma unroll
    for (int mt = 0; mt < 2; ++mt) *(LAS v2u*)(ST + c * STP + 16 * (2 * wi + mt) + 4 * g) = (v2u){0u, 0u};
    pg8::f32x4 Sacc[2] = {{0.f, 0.f, 0.f, 0.f}, {0.f, 0.f, 0.f, 0.f}};
    GdnStage A, B;
    gdn_stage_load(A, p, h, tid, offu); gdn_stage_write(A, IMG, tid);
    gdn_stage_load(B, p, 4 + h, tid, offu);
    LDS_BAR();
    constexpr int NCH = T / 64;
#define GDN_STEP2(X, Y, n_) do { const int cur = (n_) & 1; const LAS unsigned short* im = IMG + cur * GI_SZ; bf16x8_t sf[4]; \
        _Pragma("unroll") for (int ks = 0; ks < 4; ++ks) sf[ks] = *(const LAS bf16x8_t*)(ST + cur * 16 * STP + c * STP + 32 * ks + 8 * g); \
        pg8::f32x4 vn = {X.u[0], X.u[1], X.u[2], X.u[3]}; const float dl = X.dl; \
        _Pragma("unroll") for (int ks = 0; ks < 4; ++ks) vn = __builtin_amdgcn_mfma_f32_16x16x32_bf16(*(const LAS bf16x8_t*)(im + GI_NW + (16 * wi + c) * 136 + 32 * ks + 8 * g), sf[ks], vn, 0, 0, 0); \
        { v2u w; w.x = pk2(vn[0], vn[1]); w.y = pk2(vn[2], vn[3]); *(LAS v2u*)(VNT + c * VNP + 16 * wi + 4 * g) = w; } \
        pg8::f32x4 o = {0.f, 0.f, 0.f, 0.f}; \
        _Pragma("unroll") for (int ks = 0; ks < 4; ++ks) o = __builtin_amdgcn_mfma_f32_16x16x32_bf16(*(const LAS bf16x8_t*)(im + GI_QG + (16 * wi + c) * 136 + 32 * ks + 8 * g), sf[ks], o, 0, 0, 0); \
        LDS_BAR(); \
        gdn_stage_load(X, p, (((n_) + 2 < NCH) ? (n_) + 2 : (n_)) * 4 + h, tid, offu); \
        const bf16x8_t v0 = *(const LAS bf16x8_t*)(VNT + c * VNP + 8 * g), v1 = *(const LAS bf16x8_t*)(VNT + c * VNP + 32 + 8 * g); \
        o = __builtin_amdgcn_mfma_f32_16x16x32_bf16(*(const LAS bf16x8_t*)(im + GI_AT + (16 * wi + c) * 72 + 8 * g), v0, o, 0, 0, 0); \
        o = __builtin_amdgcn_mfma_f32_16x16x32_bf16(*(const LAS bf16x8_t*)(im + GI_AT + (16 * wi + c) * 72 + 32 + 8 * g), v1, o, 0, 0, 0); \
        { const size_t tb = (size_t)(n_) * 64 + 16 * wi + 4 * g; _Pragma("unroll") for (int r = 0; r < 4; ++r) GO[(tb + r) * BW + h * 128 + 16 * sl + c] = o[r]; } \
        _Pragma("unroll") for (int mt = 0; mt < 2; ++mt) { Sacc[mt] = Sacc[mt] * dl; \
            Sacc[mt] = __builtin_amdgcn_mfma_f32_16x16x32_bf16(*(const LAS bf16x8_t*)(im + GI_KT + (16 * (2 * wi + mt) + c) * 72 + 8 * g), v0, Sacc[mt], 0, 0, 0); \
            Sacc[mt] = __builtin_amdgcn_mfma_f32_16x16x32_bf16(*(const LAS bf16x8_t*)(im + GI_KT + (16 * (2 * wi + mt) + c) * 72 + 32 + 8 * g), v1, Sacc[mt], 0, 0, 0); \
            v2u w; w.x = pk2(Sacc[mt][0], Sacc[mt][1]); w.y = pk2(Sacc[mt][2], Sacc[mt][3]); *(LAS v2u*)(ST + (cur ^ 1) * 16 * STP + c * STP + 16 * (2 * wi + mt) + 4 * g) = w; } \
        gdn_stage_write(Y, IMG + (cur ^ 1) * GI_SZ, tid); \
        LDS_BAR(); } while (0)
    for (int n = 0; n < NCH; n += 2) { GDN_STEP2(A, B, n); GDN_STEP2(B, A, n + 1); }
#undef GDN_STEP2
}
constexpr int MI_Q = 0, MI_S = 4608, MI_K = 9216, MI_SZ = 13824;
struct MlStage { v4u r[3]; bf16x8_t vt[2]; float fl; };
__device__ __forceinline__ void ml_stage_load(MlStage& Sg, const Params& p, int item, int tid, int offV) {
    const bf16* MQ = (const bf16*)(p.ws + WS_MQ) + (size_t)item * 4096; const bf16* MS = (const bf16*)(p.ws + WS_MS) + (size_t)item * 4096; const bf16* MK = (const bf16*)(p.ws + WS_MK) + (size_t)item * 4096;
    const bf16* MV = (const bf16*)(p.ws + WS_MV) + (size_t)item * 9216;
    Sg.r[0] = *(const v4u*)(MQ + 8 * tid); Sg.r[1] = *(const v4u*)(MS + 8 * tid); Sg.r[2] = *(const v4u*)(MK + 8 * tid);
    Sg.vt[0] = *(const bf16x8_t*)(MV + offV); Sg.vt[1] = *(const bf16x8_t*)(MV + offV + 32);
    Sg.fl = ((const float*)(p.ws + WS_MFL))[item];
}
__device__ __forceinline__ void ml_stage_write(const MlStage& Sg, LAS unsigned short* img, int tid) {
    const int o = (tid >> 3) * 72 + 8 * (tid & 7);
    *(LAS v4u*)(img + MI_Q + o) = Sg.r[0]; *(LAS v4u*)(img + MI_S + o) = Sg.r[1]; *(LAS v4u*)(img + MI_K + o) = Sg.r[2];
}
__device__ __forceinline__ void ml_seq2(const Params& p, LAS unsigned char* lds, int wgi, int tid, int wave, int lane) {
    const int h = wgi / 5, sl0 = 2 * (wgi % 5) + (wave >> 2), wi = wave & 3, g = lane >> 4, c = lane & 15;
    const bool real = sl0 < 9; const int sl = real ? sl0 : 8;
    LAS unsigned short* IMG = (LAS unsigned short*)lds;
    LAS unsigned short* CT = (LAS unsigned short*)(lds + SEQ_UOFF + (wave >> 2) * 8192);
    float* HO = (float*)(p.ws + WS_HO); float* HDEN = (float*)(p.ws + WS_HDEN);
    const int offV = (16 * sl + c) * 64 + 8 * g;
    *(LAS v2u*)(CT + c * 72 + 16 * wi + 4 * g) = (v2u){0u, 0u};
    pg8::f32x4 Cacc = {0.f, 0.f, 0.f, 0.f};
    MlStage A, B;
    ml_stage_load(A, p, h, tid, offV); ml_stage_write(A, IMG, tid);
    ml_stage_load(B, p, 4 + h, tid, offV);
    LDS_BAR();
    constexpr int NCH = T / 64;
#define ML_STEP2(X, Y, n_) do { const int cur = (n_) & 1; const LAS unsigned short* im = IMG + cur * MI_SZ; const int ro = (16 * wi + c) * 72 + 8 * g; \
        const bf16x8_t c0 = *(const LAS bf16x8_t*)(CT + cur * 16 * 72 + c * 72 + 8 * g), c1 = *(const LAS bf16x8_t*)(CT + cur * 16 * 72 + c * 72 + 32 + 8 * g); \
        const bf16x8_t vt0 = X.vt[0], vt1 = X.vt[1]; const float fl = X.fl; \
        pg8::f32x4 num = {0.f, 0.f, 0.f, 0.f}; \
        num = __builtin_amdgcn_mfma_f32_16x16x32_bf16(*(const LAS bf16x8_t*)(im + MI_Q + ro), c0, num, 0, 0, 0); num = __builtin_amdgcn_mfma_f32_16x16x32_bf16(*(const LAS bf16x8_t*)(im + MI_Q + ro + 32), c1, num, 0, 0, 0); \
        num = __builtin_amdgcn_mfma_f32_16x16x32_bf16(*(const LAS bf16x8_t*)(im + MI_S + ro), vt0, num, 0, 0, 0); num = __builtin_amdgcn_mfma_f32_16x16x32_bf16(*(const LAS bf16x8_t*)(im + MI_S + ro + 32), vt1, num, 0, 0, 0); \
        Cacc = Cacc * fl; \
        Cacc = __builtin_amdgcn_mfma_f32_16x16x32_bf16(*(const LAS bf16x8_t*)(im + MI_K + ro), vt0, Cacc, 0, 0, 0); Cacc = __builtin_amdgcn_mfma_f32_16x16x32_bf16(*(const LAS bf16x8_t*)(im + MI_K + ro + 32), vt1, Cacc, 0, 0, 0); \
        ml_stage_load(X, p, (((n_) + 2 < NCH) ? (n_) + 2 : (n_)) * 4 + h, tid, offV); \
        { v2u w; w.x = pk2(Cacc[0], Cacc[1]); w.y = pk2(Cacc[2], Cacc[3]); *(LAS v2u*)(CT + (cur ^ 1) * 16 * 72 + c * 72 + 16 * wi + 4 * g) = w; } \
        { const size_t tb = (size_t)(n_) * 64 + 16 * wi + 4 * g; \
          if (sl < 8) { _Pragma("unroll") for (int r = 0; r < 4; ++r) HO[(tb + r) * BW + h * 128 + 16 * sl + c] = num[r]; } \
          else if (c == 0 && real) { _Pragma("unroll") for (int r = 0; r < 4; ++r) HDEN[(tb + r) * 4 + h] = num[r]; } } \
        ml_stage_write(Y, IMG + (cur ^ 1) * MI_SZ, tid); \
        LDS_BAR(); } while (0)
    for (int n = 0; n < NCH; n += 2) { ML_STEP2(A, B, n); ML_STEP2(B, A, n + 1); }
#undef ML_STEP2
}

__device__ __forceinline__ void mixer_gmlp_item(const Params& p, int l, LAS unsigned char* lds, int item, int tid, int wave, int lane) {
    const int chunk = item >> 2, g = item & 3; const size_t tok0 = (size_t)chunk * 128;
    const bf16* Z = (const bf16*)(p.ws + WS_Z); bf16* BR1 = (bf16*)(p.ws + WS_BR) + 1 * BW;
    const float* ng = p.in[I_GMNG] + l * BW; const float* nb = p.in[I_GMNB] + l * BW;
    const float* wsp = p.in[I_GMWS] + ((size_t)(l * 4 + g) * 128) * 128; const float* bsp = p.in[I_GMBS] + (l * 4 + g) * 128;
    LAS float* vn = (LAS float*)lds;
    for (int r = 0; r < 16; ++r) { const int tk = wave * 16 + r;
        const v4u raw = *(const v4u*)(Z + (tok0 + tk) * ZC + ZC_GMV + 8 * lane); float x[8]; unpack8(raw, x); float s = 0.f;
#pragma unroll
        for (int i = 0; i < 8; ++i) { x[i] = gelu_tanh(x[i]); s += x[i]; }
        const float mean = wave_sum(s) * (1.f / 512.f); float ss = 0.f;
#pragma unroll
        for (int i = 0; i < 8; ++i) { x[i] -= mean; ss += x[i] * x[i]; }
        const float rstd = rsqrtf(wave_sum(ss) * (1.f / 512.f) + LN_EPS);
        if ((lane >> 4) == g) { const int cl = 8 * (lane & 15);
#pragma unroll
            for (int i = 0; i < 8; ++i) vn[tk * 128 + cl + i] = x[i] * rstd * ng[8 * lane + i] + nb[8 * lane + i]; }
    }
    __syncthreads();
    const int t = tid >> 2, cq = tid & 3; float acc[32];
#pragma unroll
    for (int i = 0; i < 32; ++i) acc[i] = 0.f;
    const float* wrow = wsp + (size_t)t * 128;
    for (int s = 0; s <= t; ++s) { const float w = wrow[s]; const LAS float* row = vn + s * 128 + cq * 32;
#pragma unroll
        for (int i4 = 0; i4 < 8; ++i4) { const v4f a = *(const LAS v4f*)(row + 4 * i4); acc[4 * i4] += w * a.x; acc[4 * i4 + 1] += w * a.y; acc[4 * i4 + 2] += w * a.z; acc[4 * i4 + 3] += w * a.w; } }
    const float bias = bsp[t];
#pragma unroll
    for (int i8 = 0; i8 < 4; ++i8) { const v4u raw = *(const v4u*)(Z + (tok0 + t) * ZC + ZC_GMU + g * 128 + cq * 32 + 8 * i8); float u[8]; unpack8(raw, u); float o[8];
#pragma unroll
        for (int i = 0; i < 8; ++i) o[i] = gelu_tanh(u[i]) * (acc[8 * i8 + i] + bias);
#if MERGE_FP8
        *(v2u*)((unsigned char*)(p.ws + WS_BR) + (tok0 + t) * BRW + 1 * BW + g * 128 + cq * 32 + 8 * i8) = (v2u){pk4_f8(o[0], o[1], o[2], o[3], BRSC), pk4_f8(o[4], o[5], o[6], o[7], BRSC)}; }
#else
        v4u w; w.x = pk2(o[0], o[1]); w.y = pk2(o[2], o[3]); w.z = pk2(o[4], o[5]); w.w = pk2(o[6], o[7]);
        *(v4u*)(BR1 + (tok0 + t) * BRW + g * 128 + cq * 32 + 8 * i8) = w; }
#endif
    __syncthreads();
}

__device__ __forceinline__ void vt_item(const Params& p, LAS unsigned char* lds, int item, int tid) {
    const int h = item & 3, n = item >> 2; const size_t t0 = (size_t)n * 64;
    const bf16* Z = (const bf16*)(p.ws + WS_Z); bf16* VT = (bf16*)(p.ws + WS_VT);
    LAS unsigned short* vs = (LAS unsigned short*)lds;
#pragma unroll
    for (int r = 0; r < 2; ++r) { const int idx = tid + 512 * r, tk = idx >> 4, c8 = idx & 15;
        *(LAS v4u*)(vs + tk * 136 + 8 * c8) = *(const v4u*)(Z + (t0 + tk) * ZC + ZC_SBV + h * 128 + 8 * c8); }
    __syncthreads();
    { const int d = tid >> 2, jq = tid & 3; unsigned w[8];
#pragma unroll
      for (int x = 0; x < 8; ++x) w[x] = (unsigned)vs[(16 * jq + 2 * x) * 136 + d] | ((unsigned)vs[(16 * jq + 2 * x + 1) * 136 + d] << 16);
      bf16* dst = VT + ((size_t)h * 128 + d) * T + t0 + 16 * jq;
      *(v4u*)dst = (v4u){w[0], w[1], w[2], w[3]}; *(v4u*)(dst + 8) = (v4u){w[4], w[5], w[6], w[7]}; }
    __syncthreads();
}
constexpr int KTP = 136, VTP = 72;
__device__ __forceinline__ void sb_unit(const Params& p, LAS unsigned char* lds, int unit, int tid, int wave, int lane) {
    const int h = unit >> 6, q0 = (unit & 63) * 128, g = lane >> 4, c = lane & 15; const int qrow = q0 + 16 * wave + c;
    const bf16* Z = (const bf16*)(p.ws + WS_Z); const bf16* VT = (const bf16*)(p.ws + WS_VT) + (size_t)h * 128 * T; bf16* BR0 = (bf16*)(p.ws + WS_BR);
    LAS unsigned short* Kt = (LAS unsigned short*)lds;
    LAS unsigned short* Vt = Kt + 2 * 64 * KTP;
    LAS int* flags = (LAS int*)(Vt + 2 * 128 * VTP);
    bf16x8_t qf[4];
#pragma unroll
    for (int ks = 0; ks < 4; ++ks) qf[ks] = *(const bf16x8_t*)(Z + (size_t)qrow * ZC + ZC_SBQ + h * 128 + 32 * ks + 8 * g);
    pg8::f32x4 acc[8];
#pragma unroll
    for (int dt = 0; dt < 8; ++dt) acc[dt] = (pg8::f32x4){0.f, 0.f, 0.f, 0.f};
    float racc = 0.f;
    v4u kr[2], vr[2];
    const int jt = (q0 >> 6) + 1;
#define SB_GLOAD(j_) do { _Pragma("unroll") for (int r = 0; r < 2; ++r) { const int idx = tid + 512 * r; \
        kr[r] = *(const v4u*)(Z + (size_t)(64 * (j_) + (idx >> 4)) * ZC + ZC_SBK + h * 128 + 8 * (idx & 15)); \
        vr[r] = *(const v4u*)(VT + (size_t)(idx >> 3) * T + 64 * (j_) + 8 * (idx & 7)); } } while (0)
#define SB_LWRITE(b_) do { _Pragma("unroll") for (int r = 0; r < 2; ++r) { const int idx = tid + 512 * r; \
        *(LAS v4u*)(Kt + (b_) * 64 * KTP + (idx >> 4) * KTP + 8 * (idx & 15)) = kr[r]; *(LAS v4u*)(Vt + (b_) * 128 * VTP + (idx >> 3) * VTP + 8 * (idx & 7)) = vr[r]; } } while (0)
    LDS_BAR();
    SB_GLOAD(jt); SB_LWRITE(0);
    LDS_BAR();
    for (int j = jt, it = 0; j >= 0; --j, ++it) {
        const int cur = it & 1;
        SB_GLOAD(j > 0 ? j - 1 : 0);
        const bool wdone = __all(racc > 104.f);
        if (64 * j < q0 + 16 * wave + 15 && !wdone) {
            const LAS unsigned short* Kc = Kt + cur * 64 * KTP; const LAS unsigned short* Vc = Vt + cur * 128 * VTP;
            pg8::f32x4 z[4];
#pragma unroll
            for (int s = 0; s < 4; ++s) { z[s] = (pg8::f32x4){0.f, 0.f, 0.f, 0.f};
#pragma unroll
                for (int ks = 0; ks < 4; ++ks) z[s] = __builtin_amdgcn_mfma_f32_16x16x32_bf16(*(const LAS bf16x8_t*)(Kc + (16 * s + c) * KTP + 32 * ks + 8 * g), qf[ks], z[s], 0, 0, 0); }
            float sp[4][4], t[4], xs[4]; bool mk[4][4];
#pragma unroll
            for (int s = 0; s < 4; ++s) { t[s] = 0.f;
#pragma unroll
                for (int r = 0; r < 4; ++r) { const int key = 64 * j + 16 * s + 4 * g + r; mk[s][r] = key < qrow; const float zz = z[s][r] * 0.08838834764831845f; z[s][r] = zz;
                    sp[s][r] = mk[s][r] ? softplusf_(zz) : 0.f; t[s] += sp[s][r]; } }
            float grand = 0.f, higher[4];
#pragma unroll
            for (int s = 3; s >= 0; --s) { float x = t[s]; float y = __shfl(x, lane + 16); x += (g < 3) ? y : 0.f; y = __shfl(x, lane + 32); x += (g < 2) ? y : 0.f;
                xs[s] = x - t[s];
                const float tot = __shfl(x, c); higher[s] = grand; grand += tot; }
            bf16x8_t pf[2];
#pragma unroll
            for (int s = 0; s < 4; ++s) { float a[4]; float e = 0.f;
#pragma unroll
                for (int r = 3; r >= 0; --r) { const float la = z[s][r] - sp[s][r] - (racc + higher[s] + xs[s] + e); a[r] = mk[s][r] ? __expf(la) : 0.f; e += sp[s][r]; }
                const unsigned w0 = pk2(a[0], a[1]), w1 = pk2(a[2], a[3]);
                if ((s & 1) == 0) { pf[s >> 1][0] = (short)(w0 & 0xffff); pf[s >> 1][1] = (short)(w0 >> 16); pf[s >> 1][2] = (short)(w1 & 0xffff); pf[s >> 1][3] = (short)(w1 >> 16); }
                else              { pf[s >> 1][4] = (short)(w0 & 0xffff); pf[s >> 1][5] = (short)(w0 >> 16); pf[s >> 1][6] = (short)(w1 & 0xffff); pf[s >> 1][7] = (short)(w1 >> 16); } }
            racc += grand;
#pragma unroll
            for (int dt = 0; dt < 8; ++dt)
#pragma unroll
                for (int k2 = 0; k2 < 2; ++k2) { const v2u lo = *(const LAS v2u*)(Vc + (16 * dt + c) * VTP + 32 * k2 + 4 * g), hi = *(const LAS v2u*)(Vc + (16 * dt + c) * VTP + 32 * k2 + 16 + 4 * g);
                    const v4u vv = (v4u){lo.x, lo.y, hi.x, hi.y};
                    acc[dt] = __builtin_amdgcn_mfma_f32_16x16x32_bf16(__builtin_bit_cast(bf16x8_t, vv), pf[k2], acc[dt], 0, 0, 0); }
        }
        const bool wd2 = __all(racc > 104.f);
        if (lane == 0) flags[cur * 8 + wave] = wd2 ? 1 : 0;
        SB_LWRITE(cur ^ 1);
        LDS_BAR();
        int alld = 1;
#pragma unroll
        for (int w = 0; w < 8; ++w) alld &= flags[cur * 8 + w];
        if (alld) break;
    }
#undef SB_GLOAD
#undef SB_LWRITE
#pragma unroll
#if MERGE_FP8
    for (int dt = 0; dt < 8; ++dt) *(unsigned*)((unsigned char*)BR0 + (size_t)qrow * BRW + h * 128 + 16 * dt + 4 * g) = pk4_f8(acc[dt][0], acc[dt][1], acc[dt][2], acc[dt][3], BRSC);
#else
    for (int dt = 0; dt < 8; ++dt) { v2u w; w.x = pk2(acc[dt][0], acc[dt][1]); w.y = pk2(acc[dt][2], acc[dt][3]); *(v2u*)(BR0 + (size_t)qrow * BRW + h * 128 + 16 * dt + 4 * g) = w; }
#endif
}

__device__ __forceinline__ void phase_mixers(const Params& p, int l, LAS unsigned char* lds, int wg, int G, int tid, int wave, int lane, const XcdBarrier& bar) {
#if defined(PROBE_SPLIT)
    if (wg < 16) gdn_seq2(p, lds, wg, tid, wave, lane); else if (wg < 36) ml_seq2(p, lds, wg - 16, tid, wave, lane);
    xcd_barrier(bar);
    const int w2 = wg, G2 = G;
#else
    if (wg < 16) { gdn_seq2(p, lds, wg, tid, wave, lane); return; }
    if (wg < 36) { ml_seq2(p, lds, wg - 16, tid, wave, lane); return; }
    const int w2 = wg - 36, G2 = G - 36;
#endif
    for (int it = w2; it < 256; it += G2) mixer_gmlp_item(p, l, lds, it, tid, wave, lane);
    for (int it = w2; it < 256; it += G2) sb_unit(p, lds, it, tid, wave, lane);
#if !defined(PROBE_CONV0)
    __syncthreads();
    {
        constexpr int NIT1 = (NEX * 2 * (D / 64) * (ED / 32)) + (NEX * (ED / 64) * (D / 32));
        const int nheavy = (G2 < 256 && 2 * G2 >= 256) ? 256 - G2 : 0, per_wave = NIT1 / (G2 * 8);
        const int NA = (nheavy > 0 && per_wave > 2 * CONV_SKIP) ? (per_wave - CONV_SKIP) * (G2 * 8) : NIT1;
        phase_convert<1>(p, l, lds, w2 * 8 + wave, G2 * 8, wave, lane, false, 0, NA);
        if (NA < NIT1 && w2 >= nheavy) phase_convert<1>(p, l, lds, (w2 - nheavy) * 8 + wave, (G2 - nheavy) * 8, wave, lane, false, NA, NIT1); }
#endif
}

__device__ __forceinline__ void phase_post(const Params& p, int l, int gw, int NGW, int lane) {
    const bf16* Z = (const bf16*)(p.ws + WS_Z); const float* GO = (const float*)(p.ws + WS_GO); const float* HO = (const float*)(p.ws + WS_HO); const float* HDEN = (const float*)(p.ws + WS_HDEN);
    bf16* BR2 = (bf16*)(p.ws + WS_BR) + 2 * BW; bf16* BR3 = (bf16*)(p.ws + WS_BR) + 3 * BW;
    const float* gng = p.in[I_GDNNG] + l * 128; const float* mng = p.in[I_MLNG] + l * BW;
    for (int t = gw; t < T; t += NGW) {
        {   const v4f a0 = *(const v4f*)(GO + (size_t)t * BW + 8 * lane), a1 = *(const v4f*)(GO + (size_t)t * BW + 8 * lane + 4); float o[8] = {a0.x, a0.y, a0.z, a0.w, a1.x, a1.y, a1.z, a1.w}; float ss = 0.f;
#pragma unroll
            for (int i = 0; i < 8; ++i) ss += o[i] * o[i];
            const float r = rsqrtf(sum16(ss) * (1.f / 128.f) + LN_EPS);
            const v4u graw = *(const v4u*)(Z + (size_t)t * ZC + ZC_GDNG + 8 * lane); float gt[8]; unpack8(graw, gt);
#pragma unroll
            for (int i = 0; i < 8; ++i) o[i] = o[i] * r * gng[(8 * lane + i) & 127] * siluf_(gt[i]);
#if MERGE_FP8
            *(v2u*)((unsigned char*)(p.ws + WS_BR) + (size_t)t * BRW + 2 * BW + 8 * lane) = (v2u){pk4_f8(o[0], o[1], o[2], o[3], BRSC), pk4_f8(o[4], o[5], o[6], o[7], BRSC)}; }
#else
            v4u w; w.x = pk2(o[0], o[1]); w.y = pk2(o[2], o[3]); w.z = pk2(o[4], o[5]); w.w = pk2(o[6], o[7]); *(v4u*)(BR2 + (size_t)t * BRW + 8 * lane) = w; }
#endif
        {   const v4f a0 = *(const v4f*)(HO + (size_t)t * BW + 8 * lane), a1 = *(const v4f*)(HO + (size_t)t * BW + 8 * lane + 4); float o[8] = {a0.x, a0.y, a0.z, a0.w, a1.x, a1.y, a1.z, a1.w}; float ss = 0.f;
            const float dn = __builtin_amdgcn_rcpf(fmaxf(fabsf(HDEN[(size_t)t * 4 + (lane >> 4)]), 1.f));
#pragma unroll
            for (int i = 0; i < 8; ++i) { o[i] *= dn; ss += o[i] * o[i]; }
            const float r = rsqrtf(sum16(ss) * (1.f / 128.f) + LN_EPS);
            const v4u graw = *(const v4u*)(Z + (size_t)t * ZC + ZC_MLO + 8 * lane); float gt[8]; unpack8(graw, gt);
#pragma unroll
            for (int i = 0; i < 8; ++i) o[i] = o[i] * r * mng[8 * lane + i] * sigmoidf_(gt[i]);
#if MERGE_FP8
            *(v2u*)((unsigned char*)(p.ws + WS_BR) + (size_t)t * BRW + 3 * BW + 8 * lane) = (v2u){pk4_f8(o[0], o[1], o[2], o[3], BRSC), pk4_f8(o[4], o[5], o[6], o[7], BRSC)}; }
#else
            v4u w; w.x = pk2(o[0], o[1]); w.y = pk2(o[2], o[3]); w.z = pk2(o[4], o[5]); w.w = pk2(o[6], o[7]); *(v4u*)(BR3 + (size_t)t * BRW + 8 * lane) = w; }
#endif
    }
}

__device__ __forceinline__ void ln_row(const float* yrow, const float* g, const float* b, int lane, v4f (&v)[8]) {
    const v4f* yr = (const v4f*)yrow + lane; float s = 0.f;
#pragma unroll
    for (int j = 0; j < 8; ++j) { v[j] = yr[64 * j]; s += (v[j].x + v[j].y) + (v[j].z + v[j].w); }
    const float mean = wave_sum(s) * (1.f / D); float s2 = 0.f;
#pragma unroll
    for (int j = 0; j < 8; ++j) { v[j] = v[j] - mean; s2 += (v[j].x * v[j].x + v[j].y * v[j].y) + (v[j].z * v[j].z + v[j].w * v[j].w); }
    const float rstd = rsqrtf(wave_sum(s2) * (1.f / D) + LN_EPS);
#pragma unroll
    for (int j = 0; j < 8; ++j) { const v4f gg = ((const v4f*)g)[lane + 64 * j], bb = ((const v4f*)b)[lane + 64 * j]; v[j] = v[j] * rstd * gg + bb; }
}
constexpr int RT_XP = 2052;
constexpr int RT_TAB = 131072 + 1024;
__device__ __forceinline__ void phase_ln1_router(const Params& p, int l, LAS unsigned char* lds, int wg, int G, int wave, int lane, int cnt_shift = 0) {
    const bf16* Y = (const bf16*)(p.ws + WS_Y); bf16* X1 = (bf16*)(p.ws + WS_X1); bf16* X1B = (bf16*)(p.ws + WS_X1B); int* LIST = (int*)(p.ws + WS_LIST); float* WL = (float*)(p.ws + WS_WL); unsigned* SLOT = (unsigned*)(p.ws + WS_SLOT);
    unsigned* cnt = (unsigned*)(p.ws + WS_CTL) + CW_CNT + l * 4096 + cnt_shift;
    const float* g1 = p.in[I_LN1G] + (size_t)l * D; const float* b1 = p.in[I_LN1B] + (size_t)l * D;
    const float* wr = p.in[I_WR] + (size_t)l * D * NE; const float rbias = p.in[I_RB][l * NE + lane];
    LAS float* xt = (LAS float*)lds;
    LAS float* part = (LAS float*)lds;
    LAS unsigned char* selm = lds + RT_TAB; LAS unsigned char* rkm = selm + 4096; LAS float* wtm = (LAS float*)(rkm + 4096); LAS unsigned* basem = (LAS unsigned*)(wtm + 4096);
    const int n_l = lane & 15, kq = lane >> 4;
    int gi = 0;
    for (int tg = wg; tg < T / 16; tg += G, ++gi) {
        {   v4f va[8], vb[8]; const size_t m0 = (size_t)tg * 16 + 2 * wave;
#pragma unroll
            for (int j = 0; j < 8; ++j) { va[j] = ld4(Y, m0 * D + 4 * lane + 256 * j, true); vb[j] = ld4(Y, (m0 + 1) * D + 4 * lane + 256 * j, true); }
            float sa = 0.f, sb = 0.f;
#pragma unroll
            for (int j = 0; j < 8; ++j) { sa += (va[j].x + va[j].y) + (va[j].z + va[j].w); sb += (vb[j].x + vb[j].y) + (vb[j].z + vb[j].w); }
            const float ma = wave_sum(sa) * (1.f / D), mb = wave_sum(sb) * (1.f / D); float qa = 0.f, qb = 0.f;
#pragma unroll
            for (int j = 0; j < 8; ++j) { va[j] = va[j] - ma; vb[j] = vb[j] - mb; qa += (va[j].x * va[j].x + va[j].y * va[j].y) + (va[j].z * va[j].z + va[j].w * va[j].w); qb += (vb[j].x * vb[j].x + vb[j].y * vb[j].y) + (vb[j].z * vb[j].z + vb[j].w * vb[j].w); }
            const float ra = rsqrtf(wave_sum(qa) * (1.f / D) + LN_EPS), rb = rsqrtf(wave_sum(qb) * (1.f / D) + LN_EPS);
#pragma unroll
            for (int j = 0; j < 8; ++j) { const v4f gg = ((const v4f*)g1)[lane + 64 * j], bb = ((const v4f*)b1)[lane + 64 * j]; va[j] = va[j] * ra * gg + bb; vb[j] = vb[j] * rb * gg + bb; }
#pragma unroll
            for (int rr = 0; rr < 2; ++rr) { const size_t m = m0 + rr; v2u* xo = (v2u*)(X1 + m * D) + lane;
#pragma unroll
                for (int j = 0; j < 8; ++j) { const v4f v = rr ? vb[j] : va[j]; xo[64 * j] = (v2u){pk2(v.x, v.y), pk2(v.z, v.w)};
#if MOE_UP_FP8
                    { unsigned w = 0; w = __builtin_amdgcn_cvt_pk_fp8_f32(v.x, v.y, w, false); w = __builtin_amdgcn_cvt_pk_fp8_f32(v.z, v.w, w, true); ((unsigned*)((unsigned char*)X1B + m * D))[lane + 64 * j] = w; }
#else
                    { v2u o; o.x = pk2(v.x, v.y); o.y = pk2(v.z, v.w); ((v2u*)(X1B + m * D))[lane + 64 * j] = o; }
#endif
                    *(LAS v4f*)(xt + (2 * wave + rr) * RT_XP + 4 * lane + 256 * j) = v; } } }
        __syncthreads();
        {   pg8::f32x4 acc[4];
#pragma unroll
            for (int i = 0; i < 4; ++i) acc[i] = (pg8::f32x4){0.f, 0.f, 0.f, 0.f};
            const float* wb = wr + (size_t)(256 * wave + 4 * kq) * NE + 4 * n_l;
            const LAS float* xa = xt + n_l * RT_XP + 256 * wave + 4 * kq;
            v4f bwa[16], bwb[16];
#define RT_LOADW(dst, sb_) do { _Pragma("unroll") for (int q = 0; q < 16; ++q) dst[q] = *(const v4f*)(wb + (size_t)(16 * (4 * (sb_) + (q >> 2)) + (q & 3)) * NE); } while (0)
#define RT_MMA(src, sb_) do { _Pragma("unroll") for (int sg = 0; sg < 4; ++sg) { const v4f a4 = *(const LAS v4f*)(xa + 16 * (4 * (sb_) + sg)); \
                _Pragma("unroll") for (int c = 0; c < 4; ++c) { const v4f b4 = src[sg * 4 + c]; const float a = c == 0 ? a4.x : c == 1 ? a4.y : c == 2 ? a4.z : a4.w; \
                    acc[0] = __builtin_amdgcn_mfma_f32_16x16x4f32(a, b4.x, acc[0], 0, 0, 0); acc[1] = __builtin_amdgcn_mfma_f32_16x16x4f32(a, b4.y, acc[1], 0, 0, 0); \
                    acc[2] = __builtin_amdgcn_mfma_f32_16x16x4f32(a, b4.z, acc[2], 0, 0, 0); acc[3] = __builtin_amdgcn_mfma_f32_16x16x4f32(a, b4.w, acc[3], 0, 0, 0); } } } while (0)
            RT_LOADW(bwa, 0);
#pragma unroll 1
            for (int h = 0; h < 2; ++h) {
                RT_LOADW(bwb, 1); RT_MMA(bwa, 0);
                if (h == 0) RT_LOADW(bwa, 2);
                RT_MMA(bwb, 1);
                wb += (size_t)128 * NE; xa += 128; asm volatile("" : "+v"(wb));
            }
#undef RT_LOADW
#undef RT_MMA
            __syncthreads();
#pragma unroll
            for (int j = 0; j < 4; ++j) *(LAS v4f*)(part + (wave * 16 + 4 * kq + j) * 64 + 4 * n_l) = (v4f){acc[0][j], acc[1][j], acc[2][j], acc[3][j]}; }
        __syncthreads();
#pragma unroll 1
        for (int rr = 0; rr < 2; ++rr) { const int lr = wave + 8 * rr; float logit = 0.f;
#pragma unroll
            for (int w = 0; w < 8; ++w) logit += part[(w * 16 + lr) * 64 + lane];
            const float s = sigmoid_div(logit), biased = s + rbias;
            const float m1 = max8(biased); const float li = (float)(lane & 7);
            const float first = min8(biased == m1 ? li : 8.f);
            const float m2 = max8(li == first ? -INFINITY : biased);
            const float gs = m1 + m2; const int myg = lane >> 3; int grank = 0;
#pragma unroll
            for (int g2 = 0; g2 < 8; ++g2) { const float o = __builtin_bit_cast(float, __builtin_amdgcn_readlane(__builtin_bit_cast(int, gs), g2 * 8)); grank += (o > gs || (o == gs && g2 < myg)) ? 1 : 0; }
            const float masked = grank < 4 ? biased : -INFINITY; int rank = 0;
#pragma unroll 8
            for (int e2 = 0; e2 < 64; ++e2) { const float o = __builtin_bit_cast(float, __builtin_amdgcn_readlane(__builtin_bit_cast(int, masked), e2)); rank += (o > masked || (o == masked && e2 < lane)) ? 1 : 0; }
            const float wsel = rank < 6 ? s : 0.f; const float tot = wave_sum(wsel);
            const int ri = gi * 16 + lr;
            selm[ri * 64 + lane] = (rank < 6) ? 1 : 0; rkm[ri * 64 + lane] = (unsigned char)rank; wtm[ri * 64 + lane] = wsel / tot * 2.5f; }
        __syncthreads();
    }
    const int nrows = gi * 16;
    if (wave == 0) { unsigned n = 0;
        for (int r = 0; r < nrows; ++r) n += selm[r * 64 + lane];
        unsigned base = 0; if (n && !(PROBE_NOATOM && cnt_shift)) base = __hip_atomic_fetch_add(cnt + 64 * lane, n, __ATOMIC_RELAXED, __HIP_MEMORY_SCOPE_AGENT);
        basem[lane] = base; }
    __syncthreads();
    for (int ri = wave; ri < nrows; ri += 8) { unsigned pos = basem[lane];
        for (int r = 0; r < ri; ++r) pos += selm[r * 64 + lane];
        if (selm[ri * 64 + lane]) { const size_t m = (size_t)(wg + (ri >> 4) * G) * 16 + (ri & 15); const int rk = rkm[ri * 64 + lane];
            LIST[lane * T + pos] = (int)m; WL[lane * T + pos] = wtm[ri * 64 + lane]; SLOT[m * 8 + rk] = ((unsigned)lane << 16) | pos; } }
    __syncthreads();
}
__device__ __forceinline__ void phase_combine_ln2(const Params& p, int l, void* dst, bool dbf, int gw, int NGW, int lane) {
    const bf16* X1 = (const bf16*)(p.ws + WS_X1); const bf16* YE = (const bf16*)(p.ws + WS_YEXP); const unsigned* SLOT = (const unsigned*)(p.ws + WS_SLOT);
    const unsigned* cnt = (const unsigned*)(p.ws + WS_CTL) + CW_CNT + l * 4096;
    const float* g2 = p.in[I_LN2G] + (size_t)l * D; const float* b2 = p.in[I_LN2B] + (size_t)l * D;
    const int tiles = ((int)cnt[64 * lane] + 255) >> 8; const float incl = wave_scan_incl((float)tiles);
    const int toff = (int)incl - tiles;
    const int tsh = __builtin_amdgcn_readlane((int)incl, 63);
    for (int m = gw; m < T; m += NGW) {
        v4f v[8];
#pragma unroll
        for (int j = 0; j < 8; ++j) v[j] = ld4(X1, (size_t)m * D + 4 * lane + 256 * j, true) * ALPHA;
#pragma unroll
        for (int k = 0; k < 7; ++k) { size_t row;
            if (k == 0) row = (size_t)tsh * 256 + m;
            else { const unsigned s = __builtin_amdgcn_readfirstlane(SLOT[(size_t)m * 8 + (k - 1)]); const int e = (int)(s >> 16); row = (size_t)__builtin_amdgcn_readlane(toff, e) * 256 + (s & 0xffffu); }
#if YEXP_FP8
            const unsigned* yr = (const unsigned*)((const unsigned char*)YE + row * D) + lane;
#pragma unroll
            for (int j = 0; j < 8; ++j) { const unsigned y = yr[64 * j]; const auto lo = __builtin_amdgcn_cvt_pk_f32_fp8(y, false), hi = __builtin_amdgcn_cvt_pk_f32_fp8(y, true);
                v[j].x += lo[0] * (1.f / YSC); v[j].y += lo[1] * (1.f / YSC); v[j].z += hi[0] * (1.f / YSC); v[j].w += hi[1] * (1.f / YSC); } }
#else
            const v2u* yr = (const v2u*)(YE + row * D) + lane;
#pragma unroll
            for (int j = 0; j < 8; ++j) { const v2u y = yr[64 * j]; v[j].x += bflo(y.x); v[j].y += bfhi(y.x); v[j].z += bflo(y.y); v[j].w += bfhi(y.y); } }
#endif
        float s = 0.f;
#pragma unroll
        for (int j = 0; j < 8; ++j) s += (v[j].x + v[j].y) + (v[j].z + v[j].w);
        const float mean = wave_sum(s) * (1.f / D); float s2 = 0.f;
#pragma unroll
        for (int j = 0; j < 8; ++j) { v[j] = v[j] - mean; s2 += (v[j].x * v[j].x + v[j].y * v[j].y) + (v[j].z * v[j].z + v[j].w * v[j].w); }
        const float rstd = rsqrtf(wave_sum(s2) * (1.f / D) + LN_EPS);
#pragma unroll
        for (int j = 0; j < 8; ++j) { const v4f gg = ((const v4f*)g2)[lane + 64 * j], bb = ((const v4f*)b2)[lane + 64 * j]; const v4f o = v[j] * rstd * gg + bb;
            if (dbf) ((v2u*)((bf16*)dst + (size_t)m * D))[lane + 64 * j] = (v2u){pk2(o.x, o.y), pk2(o.z, o.w)};
            else ((v4f*)((float*)dst + (size_t)m * D))[lane + 64 * j] = o; }
    }
}

constexpr int NPH = 11;
template <class S> struct DupOrder {
    S s; int n;
    __device__ __forceinline__ bool next(int i, Unit& u) const { return s.next(i >= n ? i - n : i, u); }
    __device__ __forceinline__ int row_token(int i, int r) const { return s.row_token(i >= n ? i - n : i, r); }
    __device__ __forceinline__ void a_ready(const Unit& u) const { s.a_ready(u); }
    __device__ __forceinline__ void done(const Unit& u) const { s.done(u); }
};
template <class S> __device__ __forceinline__ int count_units(const S& s) { Unit u; int n = 0; while (n < 64 && s.next(n, u)) ++n; return n; }
#define ORDER_T(k, T) typename std::conditional<PROBE_DUP == (k), DupOrder<T>, T>::type
template <class S> __device__ __forceinline__ DupOrder<S> make_order(const S& s, std::true_type) { DupOrder<S> d{s, count_units(s)}; d.n = count_units(s); return d; }
template <class S> __device__ __forceinline__ S make_order(const S& s, std::false_type) { return s; }
#define MAKE_ORDER(k, s) make_order(s, std::integral_constant<bool, PROBE_DUP == (k)>())
template <int l>
__device__ __forceinline__ void run_layer(const Params& p, LAS unsigned char* lds, const XcdBarrier& bar, int tid, int lane, int wave, int G, int wg, int gw, int NGW) {
    unsigned char* ws = p.ws;
    {
        const void* xin = (l == 0) ? (const void*)p.in[I_X] : (const void*)(ws + WS_XCUR);
        void* xout = (l == NL - 1) ? (void*)p.out : (void*)(ws + WS_XCUR);
#ifndef PROBE_DUP
#define PROBE_DUP (-1)
#endif
#define IS_GEMM_PH(k) ((k) == 1 || (k) == 5 || (k) == 6 || (k) == 8 || (k) == 9)
#define REP(k) _Pragma("nounroll") for (int _r = 0; _r < ((PROBE_DUP == (k) && !IS_GEMM_PH(k)) ? 2 + (p.ph_lo >> 20) : 1); ++_r)
#ifndef PH_MASK
#define PH_MASK 0x7ff
#endif
#define RUN(k) (((PH_MASK >> (k)) & 1) && p.ph_lo <= l * NPH + (k) && l * NPH + (k) < p.ph_hi)
#define SEAM(k) do { if (l * NPH + (k) + 1 < p.ph_hi) xcd_barrier(bar); } while (0)
        if (RUN(0)) { REP(0) { phase_convert<0>(p, l, lds, gw, NGW, wave, lane);
#if defined(PROBE_CONV0)
            phase_convert<1>(p, l, lds, gw, NGW, wave, lane);
#endif
 phase_xprep(p, l, xin, l > 0, lds, gw, NGW, tid, lane); } SEAM(0); }
        if (RUN(1)) { REP(1) { pg8::Gemm g{(const bf16*)(ws + WS_XB), (const bf16*)(ws + WS_WIN), T, ZC, D / 2, D / 2, D / 2}; pg8::StaticOrder S; S.init(T, ZC, G, wg);
            pg8::EpiBf16<0> E{(bf16*)(ws + WS_Z), ZC, nullptr, 0, 0, 1.f / 64.f};
            auto S2 = MAKE_ORDER(1, S); pg8::gemm_phase<pg8::EpiBf16<0>, ORDER_T(1, pg8::StaticOrder), true, true, true>(lds, g, S2, E); } SEAM(1); }
        if (RUN(2)) { REP(2) { for (int it = wg; it < 1536; it += G) { if (it < 512) gdn_pre_item(p, l, lds, it, tid, wave, lane); else if (it < 1024) ml_pre_item(p, l, lds, it - 512, tid, wave, lane); else vt_item(p, lds, it - 1024, tid); } } SEAM(2); }
        if (RUN(3)) { REP(3) { phase_mixers(p, l, lds, wg, G, tid, wave, lane, bar); } SEAM(3); }
        if (RUN(4)) { REP(4) { phase_post(p, l, gw, NGW, lane); } SEAM(4); }
        if (RUN(5)) { REP(5) { constexpr int KM = MERGE_FP8 ? BRW / 2 : BRW; pg8::Gemm g{(const bf16*)(ws + WS_BR), (const bf16*)(ws + WS_WBR), T, D, KM, KM, KM}; pg8::StaticOrder S; S.init(T, D, G, wg);
            EpiMergeH E{(const bf16*)(ws + WS_Z), (bf16*)(ws + WS_MSUM)};
            auto S2 = MAKE_ORDER(5, S); pg8::gemm_phase<EpiMergeH, ORDER_T(5, pg8::StaticOrder), true, true, MERGE_FP8 != 0>(lds, g, S2, E); } SEAM(5); }
        if (RUN(6)) { REP(6) { pg8::Gemm g{(const bf16*)(ws + WS_MSUM), (const bf16*)(ws + WS_WOUT), T, D, D / 2, D / 2, D / 2}; pg8::StaticOrder S; S.init(T, D, G, wg);
            EpiResid E{xin, (bf16*)(ws + WS_Y), 1.f / 64.f, l > 0};
            auto S2 = MAKE_ORDER(6, S); pg8::gemm_phase<EpiResid, ORDER_T(6, pg8::StaticOrder), true, true, true>(lds, g, S2, E); } SEAM(6); }
        if (RUN(7)) { REP(7) { phase_ln1_router(p, l, lds, wg, G, wave, lane, (PROBE_DUP == 7 && _r == 0) ? 16384 : 0); } SEAM(7); }
        if (RUN(8)) { REP(8) { const unsigned* cnt = (const unsigned*)(ws + WS_CTL) + CW_CNT + l * 4096; MoeTab M(lds); moe_tables(M, cnt, tid, lane, wave);
            UpOrder S{M, 0}; S.n = up_order_build(M, (const int*)(ws + WS_LIST), (const float*)(ws + WS_WL), wg, G, tid);
            constexpr int KU = MOE_UP_FP8 ? D / 2 : D;
            pg8::Gemm g{(const bf16*)(ws + WS_X1B), (const bf16*)(ws + WS_WUP), T, NEX * 1024, KU, KU, KU};
            EpiGluSparse E{(LAS const float*)M.wt, (bf16*)(ws + WS_HB)};
            auto S2 = MAKE_ORDER(8, S); pg8::gemm_phase_gather<EpiGluSparse, ORDER_T(8, UpOrder), MOE_UP_FP8 != 0>(lds, g, S2, E); } SEAM(8); }
        if (RUN(9)) { REP(9) { const unsigned* cnt = (const unsigned*)(ws + WS_CTL) + CW_CNT + l * 4096; MoeTab M(lds); moe_tables(M, cnt, tid, lane, wave);
            DownOrder S{M, G, wg, 8 * M.t[65]};
            constexpr int KD = MOE_DN_FP8 ? ED / 2 : ED;
            pg8::Gemm g{(const bf16*)(ws + WS_HB), (const bf16*)(ws + WS_WDN), HROWS, NEX * D, KD, KD, KD};
            EpiYexp E{(bf16*)(ws + WS_YEXP)};
            auto S2 = MAKE_ORDER(9, S); pg8::gemm_phase<EpiYexp, ORDER_T(9, DownOrder), true, true, MOE_DN_FP8 != 0>(lds, g, S2, E); } SEAM(9); }
        if (RUN(10)) { REP(10) { phase_combine_ln2(p, l, xout, l != NL - 1, gw, NGW, lane); } SEAM(10); }
#undef RUN
#undef SEAM
    }
}
__global__ void __launch_bounds__(512, 2) fwd_kernel(Params p) {
    extern __shared__ __attribute__((aligned(16))) unsigned char lds_raw[];
    LAS unsigned char* lds = (LAS unsigned char*)lds_raw;
    const int tid = threadIdx.x, lane = tid & 63, wave = __builtin_amdgcn_readfirstlane(tid >> 6);
    const int G = gridDim.x, wg = blockIdx.x, gw = wg * 8 + wave, NGW = G * 8;
    volatile LAS unsigned* MISC = (volatile LAS unsigned*)(lds + MISC_OFF);
    if (tid < 32) MISC[tid] = 0u;
    __syncthreads();
    unsigned* ctl = (unsigned*)(p.ws + WS_CTL);
    const bool multi = (p.ph_hi - p.ph_lo) > 1;
    XcdBarrier bar; bar.bar = ctl + CW_BAR; bar.x = 0; bar.st = nullptr;
    if (multi) bar = xcd_barrier_post(ctl + CW_BAR, MISC + 8);
    run_layer<0>(p, lds, bar, tid, lane, wave, G, wg, gw, NGW);
    run_layer<1>(p, lds, bar, tid, lane, wave, G, wg, gw, NGW);
}

#ifndef MK_MULTI_LAUNCH
#define MK_MULTI_LAUNCH 0
#endif
extern "C" void kernel_launch(void* const* d_in, const int* in_sizes, int n_in, void* d_out, int out_size, void* d_ws, size_t ws_size, hipStream_t stream) {
    static int grid = 0;
    if (grid == 0) {
        if (n_in != 27 || out_size != T * D || ws_size < WS_END) { fprintf(stderr, "kernel_launch: unexpected shapes (n_in %d out %d ws %zu need %zu)\n", n_in, out_size, ws_size, (size_t)WS_END); grid = -1; return; }
        int dev = 0, cus = 0, per_cu = 0;
        if (hipGetDevice(&dev) != hipSuccess || hipDeviceGetAttribute(&cus, hipDeviceAttributeMultiprocessorCount, dev) != hipSuccess) { grid = -1; return; }
        if (hipFuncSetAttribute((const void*)fwd_kernel, hipFuncAttributeMaxDynamicSharedMemorySize, LDS_BYTES) != hipSuccess) { fprintf(stderr, "kernel_launch: hipFuncSetAttribute failed\n"); grid = -1; return; }
        if (hipOccupancyMaxActiveBlocksPerMultiprocessor(&per_cu, (const void*)fwd_kernel, 512, LDS_BYTES) != hipSuccess || per_cu < 1) { fprintf(stderr, "kernel_launch: occupancy query says %d\n", per_cu); }
        (void)hipGetLastError();
        grid = cus;
    }
    if (grid < 0) return;
    (void)hipMemsetAsync((char*)d_ws + WS_CTL, 0, CTL_ZERO_BYTES, stream);
    Params p{};
    for (int i = 0; i < 27; ++i) p.in[i] = (const float*)d_in[i];
    p.out = (float*)d_out; p.ws = (unsigned char*)d_ws;
#if MK_MULTI_LAUNCH
    for (int ph = 0; ph < NL * NPH; ++ph) { p.ph_lo = ph; p.ph_hi = ph + 1; hipLaunchKernelGGL(fwd_kernel, dim3(grid), dim3(512), LDS_BYTES, stream, p); }
#else
    p.ph_lo = 0; p.ph_hi = NL * NPH; hipLaunchKernelGGL(fwd_kernel, dim3(grid), dim3(512), LDS_BYTES, stream, p);
#endif
}
```

```cpp
#include <hip/hip_runtime.h>
#include <cstdio>
#include <cstdint>
#include <type_traits>
namespace pg8 {
#define PG8_LAS __attribute__((address_space(3)))
typedef unsigned short bf16_t;
typedef short bf16x8 __attribute__((ext_vector_type(8)));
typedef float f32x4 __attribute__((ext_vector_type(4)));
typedef unsigned u32x4 __attribute__((ext_vector_type(4)));
constexpr int BM = 256, BK = 64, HALF = 128, HTB = HALF * BK * 2  , STAGE_BYTES = 8 * HTB, NXCD = 8, WGM = 8;

__host__ __device__ __forceinline__ int lds_byte(int r, int c) { const int st = (r >> 4) * 2 + (c >> 5), rr = r & 15, cc = c & 31, ob = rr * 64 + cc * 2; return st * 1024 + (ob ^ (((ob >> 9) & 1) << 5)); }
__host__ __device__ __forceinline__ void stage_rc(int b, int& R, int& C) { const int st = b / 1024, sb = b % 1024, swz = sb ^ (((sb >> 9) & 1) << 5); R = (st >> 1) * 16 + swz / 64; C = (st & 1) * 32 + (swz % 64) / 2; }
__host__ __device__ __forceinline__ int perm32(int rho) { const int n = rho >> 4, i = rho & 15; return 8 * (i >> 2) + 4 * n + (i & 3); }

struct Unit { int pm, pn, aux; };
struct Gemm { const bf16_t* A; const bf16_t* Bt; int M, N, K, lda, ldb; };

struct StaticOrder {
    int nM, nN, nwg, G, c;
    __host__ __device__ void init(int M, int N, int G_, int c_) { nM = M / BM; nN = N / BM; nwg = nM * nN; G = G_; c = c_; }
    __host__ __device__ bool next(int i, Unit& u) const {
        const long L = (long)i * G + c; if (L >= nwg) return false;
        int wgid = (int)L; { const int q = nwg / NXCD, r = nwg % NXCD, xcd = wgid % NXCD, off = wgid / NXCD; wgid = (xcd < r ? xcd * (q + 1) : r * (q + 1) + (xcd - r) * q) + off; }
        const int nig = WGM * nN, gid = wgid / nig, fm = gid * WGM, gsz = (nM - fm) < WGM ? (nM - fm) : WGM;
        u.pm = fm + ((wgid % nig) % gsz); u.pn = (wgid % nig) / gsz; return true;
    }
    __device__ __forceinline__ void a_ready(const Unit&) const {}
    __device__ __forceinline__ void done(const Unit&) const {}
};

__device__ __forceinline__ unsigned cvt_pk_bf16(float lo, float hi) { unsigned r; asm volatile("v_cvt_pk_bf16_f32 %0, %1, %2" : "=v"(r) : "v"(lo), "v"(hi)); return r; }
typedef float f32x2 __attribute__((ext_vector_type(2)));
__device__ __forceinline__ f32x2 gelu_pk(f32x2 v) {
    const f32x2 av = __builtin_elementwise_abs(v), d = av * 0.2316418882f + 1.0f;
    f32x2 t; t.x = __builtin_amdgcn_rcpf(d.x); t.y = __builtin_amdgcn_rcpf(d.y);
    f32x2 q = t * 0.5307027145f + (-0.7265760135f); q = q * t + 0.7107068705f; q = q * t + (-0.142248368f); q = q * t + 0.127414796f; q = q * t;
    const f32x2 s = (v * v) * (-0.72134752044f);
    f32x2 e; e.x = __builtin_amdgcn_exp2f(s.x); e.y = __builtin_amdgcn_exp2f(s.y);
    const f32x2 m = v * (q * e), r = v - m;
    f32x2 o; o.x = v.x < 0.f ? m.x : r.x; o.y = v.y < 0.f ? m.y : r.y; return o;
}

template <int ACT  > struct EpiBf16 {
    static constexpr bool PERM = true, AFTER_DRAIN = false; static constexpr int MID = 0; static_assert(ACT == 0 || ACT == 1, "EpiBf16: ACT is 0 (none) or 1 (gelu_pk)");
    bf16_t* O; int ldc; const float* bias; int split_cols; size_t split_stride; float scale0;
    __device__ __forceinline__ void operator()(const f32x4 (&acc)[2][2][4][2], const Unit& u, int wr, int wc, int fr, int fq) const {
        const int row0 = u.pm * BM + wr * 64 + fr; int colt = u.pn * BM; bf16_t* base = O;
        float sc = scale0; if (split_cols) { const int t = colt / split_cols; base += (size_t)t * split_stride; colt -= t * split_cols; if (t != 0) sc = 1.f; }
        const int col0 = colt + wc * 32 + 8 * fq, bcol0 = u.pn * BM + wc * 32 + 8 * fq;
        f32x4 bv[2][2];
#pragma unroll
        for (int bj = 0; bj < 2; ++bj)
#pragma unroll
            for (int n = 0; n < 2; ++n) bv[bj][n] = bias ? *(const f32x4*)(bias + bcol0 + bj * HALF + 4 * n) : (f32x4){0.f, 0.f, 0.f, 0.f};
#pragma unroll
        for (int ai = 0; ai < 2; ++ai)
#pragma unroll
            for (int m = 0; m < 4; ++m) { bf16_t* rowp = base + (size_t)(row0 + ai * HALF + m * 16) * ldc + col0;
#pragma unroll
                for (int bj = 0; bj < 2; ++bj) { f32x4 v0 = acc[ai][bj][m][0] + bv[bj][0], v1 = acc[ai][bj][m][1] + bv[bj][1];
                    if (ACT == 1) { f32x2 a = gelu_pk((f32x2){v0[0], v0[1]}), b = gelu_pk((f32x2){v0[2], v0[3]}), c = gelu_pk((f32x2){v1[0], v1[1]}), d = gelu_pk((f32x2){v1[2], v1[3]});
                        v0 = (f32x4){a.x, a.y, b.x, b.y}; v1 = (f32x4){c.x, c.y, d.x, d.y}; }
                    v0 = v0 * sc; v1 = v1 * sc; u32x4 w; w.x = cvt_pk_bf16(v0[0], v0[1]); w.y = cvt_pk_bf16(v0[2], v0[3]); w.z = cvt_pk_bf16(v1[0], v1[1]); w.w = cvt_pk_bf16(v1[2], v1[3]);
                    *(u32x4*)(rowp + bj * HALF) = w; } }
    }
};

typedef int i32x8 __attribute__((ext_vector_type(8)));
__device__ __forceinline__ i32x8 cat8(const bf16x8 a, const bf16x8 b) { typedef int i32x4 __attribute__((ext_vector_type(4))); const i32x4 x = __builtin_bit_cast(i32x4, a), y = __builtin_bit_cast(i32x4, b); return (i32x8){x[0], x[1], x[2], x[3], y[0], y[1], y[2], y[3]}; }
__device__ __forceinline__ bf16x8 lo8(const i32x8 v) { typedef int i32x4 __attribute__((ext_vector_type(4))); return __builtin_bit_cast(bf16x8, __builtin_shufflevector(v, v, 0, 1, 2, 3)); }
__device__ __forceinline__ bf16x8 hi8(const i32x8 v) { typedef int i32x4 __attribute__((ext_vector_type(4))); return __builtin_bit_cast(bf16x8, __builtin_shufflevector(v, v, 4, 5, 6, 7)); }
template <class Epi, class Sched, bool ALIGN_EPI = false, bool SP2 = false, bool FP8 = false>
__device__ __forceinline__ void gemm_phase(PG8_LAS unsigned char* lds, const Gemm g, const Sched& S, const Epi& E) {
    const int tid = threadIdx.x, wid = __builtin_amdgcn_readfirstlane(tid >> 6), lane = tid & 63, wr = wid >> 2, wc = wid & 3, fr = lane & 15, fq = lane >> 4;
    const int K = g.K, nt = K / BK;
    unsigned voffA[2], voffB[2];
#pragma unroll
    for (int i = 0; i < 2; ++i) { int R, C; stage_rc(tid * 16 + i * 8192, R, C); const int Rb = Epi::PERM ? ((R & ~31) + perm32(R & 31)) : R;
        voffA[i] = (unsigned)(R * g.lda + C) * 2u; voffB[i] = (unsigned)(Rb * g.ldb + C) * 2u; }
    const size_t kstep = (size_t)(BK * 2);
    const size_t hstepA = (size_t)HALF * g.lda * 2, hstepB = (size_t)HALF * g.ldb * 2;
    const size_t tstepA = 2 * hstepA, tstepB = 2 * hstepB;
    const unsigned ldsw = (unsigned)wid * 1024u;
    const int aoff = lds_byte(wr * 64 + fr, fq * 8), boff = lds_byte(wc * 32 + fr, fq * 8);
#define PG8_SA(b, h) (((b) * 2 + (h)) * HTB)
#define PG8_SB(b, h) ((4 + (b) * 2 + (h)) * HTB)
#define PG8_STAGE(bufoff, gbase, voff) do { _Pragma("unroll") for (int _i = 0; _i < 2; ++_i) \
        __builtin_amdgcn_global_load_lds((const unsigned*)((const char*)(gbase) + (voff)[_i]), (PG8_LAS unsigned*)(lds + (bufoff) + ldsw + _i * 8192), 16, 0, 0); } while (0)
#define PG8_LDA(dst, b, h) do { _Pragma("unroll") for (int m = 0; m < 4; ++m) { if constexpr (FP8) dst##8[m] = cat8(*(const PG8_LAS bf16x8*)(lds + PG8_SA(b, h) + aoff + m * 2048), *(const PG8_LAS bf16x8*)(lds + PG8_SA(b, h) + aoff + m * 2048 + 1024)); \
        else { _Pragma("unroll") for (int k = 0; k < 2; ++k) dst[m][k] = *(const PG8_LAS bf16x8*)(lds + PG8_SA(b, h) + aoff + m * 2048 + k * 1024); } } } while (0)
#define PG8_LDB(dst, b, h) do { _Pragma("unroll") for (int n = 0; n < 2; ++n) { if constexpr (FP8) dst##8[n] = cat8(*(const PG8_LAS bf16x8*)(lds + PG8_SB(b, h) + boff + n * 2048), *(const PG8_LAS bf16x8*)(lds + PG8_SB(b, h) + boff + n * 2048 + 1024)); \
        else { _Pragma("unroll") for (int k = 0; k < 2; ++k) dst[n][k] = *(const PG8_LAS bf16x8*)(lds + PG8_SB(b, h) + boff + n * 2048 + k * 1024); } } } while (0)
#define PG8_MMA(ai, bj, At, Bt) do { __builtin_amdgcn_s_setprio(1); _Pragma("unroll") for (int m = 0; m < 4; ++m) _Pragma("unroll") for (int n = 0; n < 2; ++n) { \
        if constexpr (FP8) asm volatile("v_mfma_scale_f32_16x16x128_f8f6f4 %0, %1, %2, %0, %3, %3 op_sel_hi:[0,0,0]" : "+v"(acc[ai][bj][m][n]) : "v"(Bt##8[n]), "v"(At##8[m]), "v"(fp8_unit_scale)); \
        else { _Pragma("unroll") for (int k = 0; k < 2; ++k) acc[ai][bj][m][n] = __builtin_amdgcn_mfma_f32_16x16x32_bf16(Bt[n][k], At[m][k], acc[ai][bj][m][n], 0, 0, 0); } } __builtin_amdgcn_s_setprio(0); } while (0)
#define PG8_WAIT_V(n) asm volatile("s_waitcnt vmcnt(" #n ")" ::: "memory")
#define PG8_WAIT_L(n) asm volatile("s_waitcnt lgkmcnt(" #n ")" ::: "memory")
#define PG8_BAR __builtin_amdgcn_s_barrier()
#define PG8_SCHED __builtin_amdgcn_sched_barrier(0)
    Unit cur, nxt; int ui = 0;
    if (!S.next(0, cur)) return;
    f32x4 acc[2][2][4][2];
#pragma unroll
    for (int a = 0; a < 2; ++a)
#pragma unroll
        for (int b = 0; b < 2; ++b)
#pragma unroll
            for (int m = 0; m < 4; ++m)
#pragma unroll
                for (int n = 0; n < 2; ++n) acc[a][b][m][n] = (f32x4){0.f, 0.f, 0.f, 0.f};
    int fp8_unit_scale = 0x7F7F7F7F; asm volatile("" : "+v"(fp8_unit_scale));
    bf16x8 At[4][2], B0[2][2], B1[2][2];
    i32x8 At8[4], B08[2], B18[2];
    const char* cA = (const char*)g.A + (size_t)cur.pm * tstepA; const char* cB = (const char*)g.Bt + (size_t)cur.pn * tstepB;
    S.a_ready(cur);
    if constexpr (SP2) {
        PG8_STAGE(PG8_SB(0, 0), cB, voffB); PG8_STAGE(PG8_SB(0, 1), cB + hstepB, voffB); PG8_STAGE(PG8_SA(0, 0), cA, voffA); PG8_STAGE(PG8_SA(0, 1), cA + hstepA, voffA);
        if (wr == 1) PG8_BAR;
        PG8_WAIT_V(2); PG8_BAR;
        PG8_STAGE(PG8_SB(1, 0), cB + kstep, voffB); PG8_STAGE(PG8_SA(1, 0), cA + kstep, voffA); PG8_STAGE(PG8_SB(1, 1), cB + hstepB + kstep, voffB);
        PG8_WAIT_V(6); PG8_BAR;
    } else {
        PG8_STAGE(PG8_SB(0, 0), cB, voffB); PG8_STAGE(PG8_SA(0, 0), cA, voffA); PG8_STAGE(PG8_SB(0, 1), cB + hstepB, voffB); PG8_STAGE(PG8_SA(0, 1), cA + hstepA, voffA);
        if (wr == 1) PG8_BAR;
        PG8_WAIT_V(4); PG8_BAR;
        PG8_STAGE(PG8_SB(1, 0), cB + kstep, voffB); PG8_STAGE(PG8_SA(1, 0), cA + kstep, voffA); PG8_STAGE(PG8_SB(1, 1), cB + hstepB + kstep, voffB);
        PG8_WAIT_V(6); PG8_BAR;
    }
    for (;;) {
        const bool has_next = S.next(ui + 1, nxt);
        const char* nA = has_next ? (const char*)g.A + (size_t)nxt.pm * tstepA : cA; const char* nB = has_next ? (const char*)g.Bt + (size_t)nxt.pn * tstepB : cB;
        for (int t = 0; t < nt; t += 2) {
            const bool last = (t == nt - 2);
            const char* a1 = cA + (size_t)(t + 1) * kstep;
            const char* a2 = last ? nA : cA + (size_t)(t + 2) * kstep; const char* b2 = last ? nB : cB + (size_t)(t + 2) * kstep;
            const char* a3 = a2 + kstep; const char* b3 = b2 + kstep;
            if (last && has_next) S.a_ready(nxt);
            if constexpr (SP2) {
            if constexpr (Epi::MID > 0) { if (t != 0 && (t % Epi::MID) == 0) { PG8_SCHED; if constexpr (FP8) asm volatile("s_nop 7\n\ts_nop 7" ::: "memory"); E.mid(acc, cur, t / Epi::MID, wr, wc, fr, fq); if constexpr (FP8) asm volatile("s_nop 7" ::: "memory"); PG8_SCHED; } }
            PG8_LDB(B0, 0, 0); PG8_LDB(B1, 0, 1); PG8_SCHED; PG8_LDA(At, 0, 0); PG8_STAGE(PG8_SA(1, 1), a1 + hstepA, voffA);
            PG8_WAIT_V(8); PG8_WAIT_L(0); PG8_BAR; PG8_MMA(0, 0, At, B0); PG8_MMA(0, 1, At, B1); PG8_BAR; PG8_SCHED;
            PG8_LDA(At, 0, 1); PG8_STAGE(PG8_SB(0, 0), b2, voffB); PG8_STAGE(PG8_SB(0, 1), b2 + hstepB, voffB); PG8_STAGE(PG8_SA(0, 0), a2, voffA);
            PG8_WAIT_V(8); PG8_WAIT_L(0); PG8_BAR; PG8_MMA(1, 0, At, B0); PG8_MMA(1, 1, At, B1); PG8_BAR; PG8_SCHED;
            PG8_LDB(B0, 1, 0); PG8_LDB(B1, 1, 1); PG8_SCHED; PG8_LDA(At, 1, 0); PG8_STAGE(PG8_SA(0, 1), a2 + hstepA, voffA);
            PG8_WAIT_V(8); PG8_WAIT_L(0); PG8_BAR; PG8_MMA(0, 0, At, B0); PG8_MMA(0, 1, At, B1); PG8_BAR; PG8_SCHED;
            PG8_LDA(At, 1, 1); PG8_STAGE(PG8_SB(1, 0), b3, voffB); PG8_STAGE(PG8_SB(1, 1), b3 + hstepB, voffB); PG8_STAGE(PG8_SA(1, 0), a3, voffA);
            PG8_WAIT_V(8); PG8_WAIT_L(0); PG8_BAR; PG8_MMA(1, 0, At, B0); PG8_MMA(1, 1, At, B1); PG8_BAR; PG8_SCHED;
            } else {
            PG8_LDB(B0, 0, 0); PG8_SCHED; PG8_LDA(At, 0, 0); PG8_STAGE(PG8_SA(1, 1), a1 + hstepA, voffA);
            PG8_WAIT_L(8); PG8_BAR; PG8_WAIT_L(0); PG8_MMA(0, 0, At, B0); PG8_BAR; PG8_SCHED;
            PG8_LDB(B1, 0, 1); PG8_STAGE(PG8_SB(0, 0), b2, voffB);
            PG8_BAR; PG8_WAIT_L(0); PG8_MMA(0, 1, At, B1); PG8_BAR;
            PG8_LDA(At, 0, 1); PG8_STAGE(PG8_SA(0, 0), a2, voffA);
            PG8_BAR; PG8_WAIT_L(0); PG8_MMA(1, 0, At, B0); PG8_BAR; PG8_SCHED;
            PG8_STAGE(PG8_SB(0, 1), b2 + hstepB, voffB);
            PG8_WAIT_V(6); PG8_BAR; PG8_MMA(1, 1, At, B1); PG8_BAR;
            PG8_LDB(B0, 1, 0); PG8_SCHED; PG8_LDA(At, 1, 0); PG8_STAGE(PG8_SA(0, 1), a2 + hstepA, voffA);
            PG8_WAIT_L(8); PG8_BAR; PG8_WAIT_L(0); PG8_MMA(0, 0, At, B0); PG8_BAR; PG8_SCHED;
            PG8_LDB(B1, 1, 1); PG8_STAGE(PG8_SB(1, 0), b3, voffB);
            PG8_BAR; PG8_WAIT_L(0); PG8_MMA(0, 1, At, B1); PG8_BAR;
            PG8_LDA(At, 1, 1); PG8_STAGE(PG8_SA(1, 0), a3, voffA);
            PG8_BAR; PG8_WAIT_L(0); PG8_MMA(1, 0, At, B0); PG8_BAR; PG8_SCHED;
            PG8_STAGE(PG8_SB(1, 1), b3 + hstepB, voffB);
            PG8_WAIT_V(6); PG8_BAR; PG8_MMA(1, 1, At, B1); PG8_BAR;
            }
        }
        if constexpr (ALIGN_EPI) { if (wr == 0) PG8_BAR; }
        if constexpr (FP8) asm volatile("s_nop 7\n\ts_nop 7" ::: "memory");
        if constexpr (!Epi::AFTER_DRAIN) { E(acc, cur, wr, wc, fr, fq); S.done(cur); }
        if (!has_next) break;
#pragma unroll
        for (int a = 0; a < 2; ++a)
#pragma unroll
            for (int b = 0; b < 2; ++b)
#pragma unroll
                for (int m = 0; m < 4; ++m)
#pragma unroll
                    for (int n = 0; n < 2; ++n) acc[a][b][m][n] = (f32x4){0.f, 0.f, 0.f, 0.f};
        cur = nxt; cA = nA; cB = nB; ++ui;
        if constexpr (ALIGN_EPI) { if (wr == 1) PG8_BAR; }
    }
    PG8_WAIT_V(0);
    if constexpr (!ALIGN_EPI) { if (wr == 0) PG8_BAR; }
    PG8_BAR;
    if constexpr (Epi::AFTER_DRAIN) { E.fused(acc, cur, wr, wc, fr, fq, lds, wid, lane); S.done(cur); }
#undef PG8_SA
#undef PG8_SB
#undef PG8_STAGE
#undef PG8_LDA
#undef PG8_LDB
#undef PG8_MMA
#undef PG8_WAIT_V
#undef PG8_WAIT_L
#undef PG8_BAR
#undef PG8_SCHED
}
template <class Epi, class Sched, bool FP8 = false>
__device__ __forceinline__ void gemm_phase_gather(PG8_LAS unsigned char* lds, const Gemm g, const Sched& S, const Epi& E) {
    const int tid = threadIdx.x, wid = __builtin_amdgcn_readfirstlane(tid >> 6), lane = tid & 63, wr = wid >> 2, wc = wid & 3, fr = lane & 15, fq = lane >> 4;
    const int K = g.K, nt = K / BK;
    unsigned voffB[2]; int RA[2], CA[2];
#pragma unroll
    for (int i = 0; i < 2; ++i) { int R, C; stage_rc(tid * 16 + i * 8192, R, C); const int Rb = Epi::PERM ? ((R & ~31) + perm32(R & 31)) : R;
        RA[i] = R; CA[i] = C; voffB[i] = (unsigned)(Rb * g.ldb + C) * 2u; }
    const size_t kstep = (size_t)(BK * 2);
    const size_t hstepB = (size_t)HALF * g.ldb * 2, tstepB = 2 * hstepB;
    const unsigned ldsw = (unsigned)wid * 1024u;
    const int aoff = lds_byte(wr * 64 + fr, fq * 8), boff = lds_byte(wc * 32 + fr, fq * 8);
#define PG8_SA(b, h) (((b) * 2 + (h)) * HTB)
#define PG8_SB(b, h) ((4 + (b) * 2 + (h)) * HTB)
#define PG8_STAGE(bufoff, gbase, voff) do { _Pragma("unroll") for (int _i = 0; _i < 2; ++_i) \
        __builtin_amdgcn_global_load_lds((const unsigned*)((const char*)(gbase) + (voff)[_i]), (PG8_LAS unsigned*)(lds + (bufoff) + ldsw + _i * 8192), 16, 0, 0); } while (0)
#define PG8_LDA(dst, b, h) do { _Pragma("unroll") for (int m = 0; m < 4; ++m) { if constexpr (FP8) dst##8[m] = cat8(*(const PG8_LAS bf16x8*)(lds + PG8_SA(b, h) + aoff + m * 2048), *(const PG8_LAS bf16x8*)(lds + PG8_SA(b, h) + aoff + m * 2048 + 1024)); \
        else { _Pragma("unroll") for (int k = 0; k < 2; ++k) dst[m][k] = *(const PG8_LAS bf16x8*)(lds + PG8_SA(b, h) + aoff + m * 2048 + k * 1024); } } } while (0)
#define PG8_LDB(dst, b, h) do { _Pragma("unroll") for (int n = 0; n < 2; ++n) { if constexpr (FP8) dst##8[n] = cat8(*(const PG8_LAS bf16x8*)(lds + PG8_SB(b, h) + boff + n * 2048), *(const PG8_LAS bf16x8*)(lds + PG8_SB(b, h) + boff + n * 2048 + 1024)); \
        else { _Pragma("unroll") for (int k = 0; k < 2; ++k) dst[n][k] = *(const PG8_LAS bf16x8*)(lds + PG8_SB(b, h) + boff + n * 2048 + k * 1024); } } } while (0)
#define PG8_MMA(ai, bj, At, Bt) do { __builtin_amdgcn_s_setprio(1); _Pragma("unroll") for (int m = 0; m < 4; ++m) _Pragma("unroll") for (int n = 0; n < 2; ++n) { \
        if constexpr (FP8) asm volatile("v_mfma_scale_f32_16x16x128_f8f6f4 %0, %1, %2, %0, %3, %3 op_sel_hi:[0,0,0]" : "+v"(acc[ai][bj][m][n]) : "v"(Bt##8[n]), "v"(At##8[m]), "v"(fp8_unit_scale)); \
        else { _Pragma("unroll") for (int k = 0; k < 2; ++k) acc[ai][bj][m][n] = __builtin_amdgcn_mfma_f32_16x16x32_bf16(Bt[n][k], At[m][k], acc[ai][bj][m][n], 0, 0, 0); } } __builtin_amdgcn_s_setprio(0); } while (0)
#define PG8_WAIT_V(n) asm volatile("s_waitcnt vmcnt(" #n ")" ::: "memory")
#define PG8_WAIT_L(n) asm volatile("s_waitcnt lgkmcnt(" #n ")" ::: "memory")
#define PG8_BAR __builtin_amdgcn_s_barrier()
#define PG8_SCHED __builtin_amdgcn_sched_barrier(0)
#define PG8_ROWS(dst, ui_) do { _Pragma("unroll") for (int _h = 0; _h < 2; ++_h) _Pragma("unroll") for (int _i = 0; _i < 2; ++_i) \
        dst[_h][_i] = (unsigned)S.row_token((ui_), _h * HALF + RA[_i]) * (unsigned)(g.lda * 2) + (unsigned)(CA[_i] * 2); } while (0)
    Unit cur, nxt; int ui = 0;
    if (!S.next(0, cur)) return;
    f32x4 acc[2][2][4][2];
#pragma unroll
    for (int a = 0; a < 2; ++a)
#pragma unroll
        for (int b = 0; b < 2; ++b)
#pragma unroll
            for (int m = 0; m < 4; ++m)
#pragma unroll
                for (int n = 0; n < 2; ++n) acc[a][b][m][n] = (f32x4){0.f, 0.f, 0.f, 0.f};
    int fp8_unit_scale = 0x7F7F7F7F; asm volatile("" : "+v"(fp8_unit_scale));
    bf16x8 At[4][2], B0[2][2], B1[2][2];
    i32x8 At8[4], B08[2], B18[2];
    unsigned offC[2][2];
    PG8_ROWS(offC, 0);
    const char* gA = (const char*)g.A;
    const char* cB = (const char*)g.Bt + (size_t)cur.pn * tstepB;
    PG8_STAGE(PG8_SB(0, 0), cB, voffB); PG8_STAGE(PG8_SB(0, 1), cB + hstepB, voffB); PG8_STAGE(PG8_SA(0, 0), gA, offC[0]); PG8_STAGE(PG8_SA(0, 1), gA, offC[1]);
    if (wr == 1) PG8_BAR;
    PG8_WAIT_V(2); PG8_BAR;
    PG8_STAGE(PG8_SB(1, 0), cB + kstep, voffB); PG8_STAGE(PG8_SA(1, 0), gA + kstep, offC[0]); PG8_STAGE(PG8_SB(1, 1), cB + hstepB + kstep, voffB);
    PG8_WAIT_V(6); PG8_BAR;
    for (;;) {
        const bool has_next = S.next(ui + 1, nxt);
        const char* nB = has_next ? (const char*)g.Bt + (size_t)nxt.pn * tstepB : cB;
        for (int t = 0; t < nt; t += 2) {
            const bool last = (t == nt - 2);
            const char* a1 = gA + (size_t)(t + 1) * kstep;
            const char* a2 = last ? gA : gA + (size_t)(t + 2) * kstep; const char* b2 = last ? nB : cB + (size_t)(t + 2) * kstep;
            const char* a3 = a2 + kstep; const char* b3 = b2 + kstep;
            PG8_LDB(B0, 0, 0); PG8_LDB(B1, 0, 1); PG8_SCHED; PG8_LDA(At, 0, 0); PG8_STAGE(PG8_SA(1, 1), a1, offC[1]);
            if (last && has_next) { PG8_ROWS(offC, ui + 1); }
            PG8_WAIT_V(8); PG8_WAIT_L(0); PG8_BAR; PG8_MMA(0, 0, At, B0); PG8_MMA(0, 1, At, B1); PG8_BAR; PG8_SCHED;
            PG8_LDA(At, 0, 1); PG8_STAGE(PG8_SB(0, 0), b2, voffB); PG8_STAGE(PG8_SB(0, 1), b2 + hstepB, voffB); PG8_STAGE(PG8_SA(0, 0), a2, offC[0]);
            PG8_WAIT_V(8); PG8_WAIT_L(0); PG8_BAR; PG8_MMA(1, 0, At, B0); PG8_MMA(1, 1, At, B1); PG8_BAR; PG8_SCHED;
            PG8_LDB(B0, 1, 0); PG8_LDB(B1, 1, 1); PG8_SCHED; PG8_LDA(At, 1, 0); PG8_STAGE(PG8_SA(0, 1), a2, offC[1]);
            PG8_WAIT_V(8); PG8_WAIT_L(0); PG8_BAR; PG8_MMA(0, 0, At, B0); PG8_MMA(0, 1, At, B1); PG8_BAR; PG8_SCHED;
            PG8_LDA(At, 1, 1); PG8_STAGE(PG8_SB(1, 0), b3, voffB); PG8_STAGE(PG8_SB(1, 1), b3 + hstepB, voffB); PG8_STAGE(PG8_SA(1, 0), a3, offC[0]);
            PG8_WAIT_V(8); PG8_WAIT_L(0); PG8_BAR; PG8_MMA(1, 0, At, B0); PG8_MMA(1, 1, At, B1); PG8_BAR; PG8_SCHED;
        }
        if (wr == 0) PG8_BAR;
        if constexpr (FP8) asm volatile("s_nop 7\n\ts_nop 7" ::: "memory");
        E(acc, cur, wr, wc, fr, fq); S.done(cur);
        if (!has_next) break;
#pragma unroll
        for (int a = 0; a < 2; ++a)
#pragma unroll
            for (int b = 0; b < 2; ++b)
#pragma unroll
                for (int m = 0; m < 4; ++m)
#pragma unroll
                    for (int n = 0; n < 2; ++n) acc[a][b][m][n] = (f32x4){0.f, 0.f, 0.f, 0.f};
        cur = nxt; cB = nB; ++ui;
        if (wr == 1) PG8_BAR;
    }
    PG8_WAIT_V(0);
    PG8_BAR;
#undef PG8_ROWS
#undef PG8_SA
#undef PG8_SB
#undef PG8_STAGE
#undef PG8_LDA
#undef PG8_LDB
#undef PG8_MMA
#undef PG8_WAIT_V
#undef PG8_WAIT_L
#undef PG8_BAR
#undef PG8_SCHED
}
}

#ifndef GATE_SPLIT
#define GATE_SPLIT 1
#endif
#ifndef YEXP_FP8
#define YEXP_FP8 1
#endif
#ifndef CONV_SKIP
#define CONV_SKIP 6
#endif
#ifndef MERGE_FP8
#define MERGE_FP8 1
#endif
#ifndef MOE_DN_FP8
#define MOE_DN_FP8 1
#endif
#ifndef MOE_UP_FP8
#define MOE_UP_FP8 1
#endif
#ifndef PROBE_NOATOM
#define PROBE_NOATOM 0
#endif
constexpr int T = 8192, D = 2048, NL = 2, BW = 512, ZC = 14336, INC = 14352;
constexpr int NE = 64, NEX = 65  , ED = 512;
constexpr int BRW = 4 * BW;
constexpr int HK = NEX * ED;
constexpr float ALPHA = 1.41421356237f;
constexpr float LN_EPS = 1e-5f;
constexpr float UPSC = MOE_UP_FP8 ? (1.f / 64.f) : 1.f;
constexpr float BRSC = MERGE_FP8 ? 8.f : 1.f, MGSC = MERGE_FP8 ? (1.f / (8.f * 64.f)) : 1.f;
constexpr float YSC = 64.f;
constexpr float HSC = 8.f, DNSC = MOE_DN_FP8 ? (1.f / (HSC * 64.f)) : 1.f;
constexpr int ZC_SBQ = 0, ZC_SBK = 512, ZC_SBV = 1024, ZC_GMU = 1536, ZC_GMV = 2048, ZC_GDN = 2560, ZC_GDNG = 4096,
              ZC_MLQ = 4608, ZC_MLK = 4864, ZC_MLV = 5120, ZC_MLO = 5632, ZC_GATE = 6144;

#define GAS __attribute__((address_space(1)))
#define LAS __attribute__((address_space(3)))
typedef unsigned short bf16;
typedef unsigned v4u __attribute__((ext_vector_type(4)));
typedef unsigned v2u __attribute__((ext_vector_type(2)));
typedef float v4f __attribute__((ext_vector_type(4)));
typedef float v2f __attribute__((ext_vector_type(2)));
#define LDS_WAIT() asm volatile("s_waitcnt lgkmcnt(0)" ::: "memory")
#define LDS_BAR() do { asm volatile("s_waitcnt lgkmcnt(0)" ::: "memory"); __builtin_amdgcn_s_barrier(); asm volatile("" ::: "memory"); } while (0)

constexpr size_t MiB = 1u << 20;
constexpr size_t WS_CTL = 0, CTL_ZERO_BYTES = 1 * MiB;
constexpr size_t WS_WIN = 2 * MiB, WS_WBR = 58 * MiB, WS_WOUT = 66 * MiB, WS_WUP = 74 * MiB, WS_WDN = 334 * MiB;
constexpr size_t WS_XB = 464 * MiB, WS_SMALL = 496 * MiB, WS_EG = 497 * MiB, WS_BETA = WS_EG + 256 * 1024, WS_COMB = 498 * MiB;
constexpr size_t WS_Z = 500 * MiB, WS_GQ = 724 * MiB, WS_GK = 740 * MiB, WS_GV = 756 * MiB, WS_GO = 772 * MiB, WS_HO = 788 * MiB;
constexpr size_t WS_BR = 804 * MiB, WS_MTMP = 836 * MiB, WS_MSUM = 900 * MiB, WS_Y = 932 * MiB, WS_X1 = 996 * MiB, WS_X1B = 1060 * MiB;
constexpr size_t WS_XCUR = 1092 * MiB, WS_HB = 1156 * MiB, WS_YEXP = 1236 * MiB, WS_LIST = 1524 * MiB, WS_WL = 1526 * MiB, WS_SLOT = 1528 * MiB, WS_MQ = 1530 * MiB, WS_MS = 1534 * MiB, WS_MK = 1538 * MiB, WS_MV = 1542 * MiB, WS_MFL = 1552 * MiB, WS_HDEN = WS_MFL + 65536, WS_VT = 1553 * MiB, WS_END = 1561 * MiB;
constexpr size_t WS_GU = WS_GQ, WS_GNW = WS_GK, WS_GQG = WS_GK + 8 * MiB, WS_GKT = WS_GV, WS_GAT = WS_GV + 8 * MiB, WS_GDL = WS_GV + 12 * MiB;
constexpr int HROWS = 73728;
static_assert(WS_HB + (size_t)HROWS * ED * 2 <= WS_YEXP && WS_YEXP + (size_t)HROWS * D * 2 <= WS_LIST, "ws map (moe)");
static_assert(WS_WIN + (size_t)ZC * D * 2 <= WS_WBR && WS_WUP + (size_t)NEX * 1024 * D * 2 <= WS_WDN && WS_WDN + (size_t)D * HK * 2 <= WS_XB, "ws map (weights)");
static_assert(WS_Z + (size_t)T * ZC * 2 <= WS_GQ, "ws map (acts)");
constexpr int CW_BAR = 4096, CW_CNT = 16384;
constexpr int TAB_OFF = 131072 + 1024;
constexpr int LDS_BYTES = 163840, MISC_OFF = 131072 + 320;

__device__ __forceinline__ float bflo(unsigned w) { return __uint_as_float(w << 16); }
__device__ __forceinline__ float bfhi(unsigned w) { return __uint_as_float(w & 0xffff0000u); }
__device__ __forceinline__ unsigned f2bf(float f) { unsigned u = __float_as_uint(f); return (u + 0x7fffu + ((u >> 16) & 1u)) >> 16; }
typedef __bf16 bf16n2 __attribute__((ext_vector_type(2))); typedef float f32n2 __attribute__((ext_vector_type(2)));
__device__ __forceinline__ unsigned pk2(float lo, float hi) { const bf16n2 v = __builtin_convertvector((f32n2){lo, hi}, bf16n2); return __builtin_bit_cast(unsigned, v); }
__device__ __forceinline__ unsigned pk4_f8(float a, float b, float c, float d, float sc) {
    a = __builtin_amdgcn_fmed3f(a * sc, -448.f, 448.f); b = __builtin_amdgcn_fmed3f(b * sc, -448.f, 448.f); c = __builtin_amdgcn_fmed3f(c * sc, -448.f, 448.f); d = __builtin_amdgcn_fmed3f(d * sc, -448.f, 448.f);
    unsigned w = 0; w = __builtin_amdgcn_cvt_pk_fp8_f32(a, b, w, false); w = __builtin_amdgcn_cvt_pk_fp8_f32(c, d, w, true); return w; }
__device__ __forceinline__ v4f ld4(const void* base, size_t idx, bool is_bf16) {
    if (is_bf16) { const v2u r = *(const v2u*)((const unsigned short*)base + idx); return (v4f){bflo(r.x), bfhi(r.x), bflo(r.y), bfhi(r.y)}; }
    return *(const v4f*)((const float*)base + idx); }
template <int CTRL> __device__ __forceinline__ float dpp(float x) { return __builtin_bit_cast(float, __builtin_amdgcn_mov_dpp(__builtin_bit_cast(int, x), CTRL, 0xf, 0xf, true)); }
__device__ __forceinline__ float sum4(float x) { x += dpp<0xB1>(x); x += dpp<0x4E>(x); return x; }
__device__ __forceinline__ float sum8(float x) { x = sum4(x); x += dpp<0x141>(x); return x; }
__device__ __forceinline__ float sum16(float x) { x = sum8(x); x += dpp<0x140>(x); return x; }
__device__ __forceinline__ float wave_sum(float x) { x = sum16(x); x += __shfl_xor(x, 16); x += __shfl_xor(x, 32); return x; }
__device__ __forceinline__ float max8(float x) { x = fmaxf(x, dpp<0xB1>(x)); x = fmaxf(x, dpp<0x4E>(x)); x = fmaxf(x, dpp<0x141>(x)); return x; }
__device__ __forceinline__ float min8(float x) { x = fminf(x, dpp<0xB1>(x)); x = fminf(x, dpp<0x4E>(x)); x = fminf(x, dpp<0x141>(x)); return x; }
__device__ __forceinline__ float wave_scan_incl(float v) {
    v += __builtin_bit_cast(float, __builtin_amdgcn_update_dpp(0, __builtin_bit_cast(int, v), 0x111, 0xf, 0xf, true));
    v += __builtin_bit_cast(float, __builtin_amdgcn_update_dpp(0, __builtin_bit_cast(int, v), 0x112, 0xf, 0xf, true));
    v += __builtin_bit_cast(float, __builtin_amdgcn_update_dpp(0, __builtin_bit_cast(int, v), 0x114, 0xf, 0xf, true));
    v += __builtin_bit_cast(float, __builtin_amdgcn_update_dpp(0, __builtin_bit_cast(int, v), 0x118, 0xf, 0xf, true));
    v += __builtin_bit_cast(float, __builtin_amdgcn_update_dpp(0, __builtin_bit_cast(int, v), 0x142, 0xa, 0xf, false));
    v += __builtin_bit_cast(float, __builtin_amdgcn_update_dpp(0, __builtin_bit_cast(int, v), 0x143, 0xc, 0xf, false));
    return v;
}
__device__ __forceinline__ float sigmoidf_(float x) { return __builtin_amdgcn_rcpf(1.f + __expf(-x)); }
__device__ __forceinline__ float sigmoid_div(float x) { return 1.f / (1.f + __expf(-x)); }
__device__ __forceinline__ float siluf_(float x) { return x * __builtin_amdgcn_rcpf(1.f + __expf(-x)); }
__device__ __forceinline__ float softplusf_(float x) { return fmaxf(x, 0.f) + __logf(1.f + __expf(-fabsf(x))); }
__device__ __forceinline__ float gelu_tanh(float x) { const float y = 0.7978845608f * (x + 0.044715f * x * x * x); const float t = 1.f - 2.f * __builtin_amdgcn_rcpf(__expf(2.f * y) + 1.f); return 0.5f * x * (1.f + t); }
__device__ __forceinline__ void unpack8(const v4u r, float (&f)[8]) { f[0] = bflo(r.x); f[1] = bfhi(r.x); f[2] = bflo(r.y); f[3] = bfhi(r.y); f[4] = bflo(r.z); f[5] = bfhi(r.z); f[6] = bflo(r.w); f[7] = bfhi(r.w); }
#define XB_TMO      128
#define XB_XCNT(j)  (256  + 64 * (j))
#define XB_XSUB(j)  (1280 + 64 * (j))
#define XB_XGEN(j)  (2304 + 64 * (j))
#define XB_TOP      3328
#define XB_TOPGEN   3392
#define XCD_BAR_WORDS 3456
#define XB_SPIN_CAP (1u << 18)

__device__ __forceinline__ unsigned xb_ld(unsigned* p)              { return __hip_atomic_load(p, __ATOMIC_RELAXED, __HIP_MEMORY_SCOPE_AGENT); }
__device__ __forceinline__ unsigned xb_add(unsigned* p, unsigned v) { return __hip_atomic_fetch_add(p, v, __ATOMIC_RELAXED, __HIP_MEMORY_SCOPE_AGENT); }
__device__ __forceinline__ unsigned xb_xcc_id() { return (unsigned)__builtin_amdgcn_s_getreg((3 << 11) | 20) & 0xFu; }
#define XB_SPIN(cond, bar) do { unsigned _sp = 0; while (cond) { __builtin_amdgcn_s_sleep(1); \
    if ((++_sp & 255u) == 0u) { if (xb_ld(&(bar)[XB_TMO])) break; if (_sp > XB_SPIN_CAP) { atomicAdd(&(bar)[XB_TMO], 1u); break; } } } } while (0)

struct XcdBarrier {
    unsigned* bar; unsigned x;
    volatile LAS unsigned* st;
};

__device__ __forceinline__ XcdBarrier xcd_barrier_post(unsigned* bar, volatile LAS unsigned* st) {
    XcdBarrier b; b.bar = bar; b.x = xb_xcc_id(); b.st = st;
    if (threadIdx.x == 0) (void)xb_add(&bar[XB_XCNT(b.x)], 1u);
    return b;
}
__device__ __forceinline__ void xcd_barrier_complete(unsigned* bar, unsigned x, unsigned& nloc, unsigned& nx) {
    const unsigned G = gridDim.x * gridDim.y * gridDim.z;
    unsigned sum, cnt, mine, sp = 0u;
    for (;;) {
        sum = 0u; cnt = 0u; mine = 0u;
#pragma unroll
        for (unsigned j = 0; j < 16; ++j) { const unsigned c = xb_ld(&bar[XB_XCNT(j)]); sum += c; cnt += (c > 0u) ? 1u : 0u; mine = (j == x) ? c : mine; }
        if (sum == G) break;
        __builtin_amdgcn_s_sleep(1);
        if ((++sp & 255u) == 0u) { if (xb_ld(&bar[XB_TMO])) break; if (sp > XB_SPIN_CAP) { atomicAdd(&bar[XB_TMO], 1u); break; } }
    }
    nloc = mine > 0u ? mine : 1u; nx = cnt > 0u ? cnt : 1u;
}

__device__ __forceinline__ void xcd_barrier(const XcdBarrier& b) {
    asm volatile("s_waitcnt vmcnt(0)" ::: "memory");
    __syncthreads();
    if (threadIdx.x == 0) {
        unsigned* bar = b.bar;
        __builtin_amdgcn_s_waitcnt(0);
        unsigned nloc = b.st[0], nx = b.st[1];
        if (nloc == 0u) { xcd_barrier_complete(bar, b.x, nloc, nx); b.st[0] = nloc; b.st[1] = nx; }
        const unsigned old = xb_add(&bar[XB_XSUB(b.x)], 1u);
        const unsigned gen = old / nloc;
        if (old + 1u == (gen + 1u) * nloc) {
            __builtin_amdgcn_fence(__ATOMIC_RELEASE, "agent");
            asm volatile("s_waitcnt vmcnt(0)" ::: "memory");
            const unsigned og = xb_add(&bar[XB_TOP], 1u);
            const unsigned tg = og / nx;
            if (og + 1u == (tg + 1u) * nx) xb_add(&bar[XB_TOPGEN], 1u);
            else XB_SPIN(xb_ld(&bar[XB_TOPGEN]) == tg, bar);
            __builtin_amdgcn_fence(__ATOMIC_ACQUIRE, "agent");
            xb_add(&bar[XB_XGEN(b.x)], 1u);
            asm volatile("s_waitcnt vmcnt(0)" ::: "memory");
        } else {
            XB_SPIN(xb_ld(&bar[XB_XGEN(b.x)]) == gen, bar);
            __builtin_amdgcn_fence(__ATOMIC_ACQUIRE, "agent");
            asm volatile("s_waitcnt vmcnt(0)" ::: "memory");
        }
    }
    __syncthreads();
}

struct Params { const float* in[27]; float* out; unsigned char* ws; int ph_lo, ph_hi; };
enum { I_X = 0, I_WIN, I_GMNG, I_GMNB, I_GMWS, I_GMBS, I_CONVW, I_ALOG, I_DTB, I_GDNNG, I_MLIB, I_MLFB, I_MLNG, I_WBR, I_WOUT, I_LN1G, I_LN1B,
       I_WR, I_RB, I_WG, I_WU, I_WD, I_SG, I_SU, I_SD, I_LN2G, I_LN2B };

using pg8::f32x4; using pg8::u32x4; using pg8::Unit; using pg8::HALF; using pg8::BM;

struct EpiMergeH {
    static constexpr bool PERM = true, AFTER_DRAIN = false; static constexpr int MID = MERGE_FP8 ? BW / (2 * pg8::BK) : BW / pg8::BK;
    const bf16* Z; bf16* msum;
    __device__ __forceinline__ void mid(f32x4 (&acc)[2][2][4][2], const Unit& u, int j, int wr, int wc, int fr, int fq) const {
        int row0 = u.pm * BM + wr * 64 + fr; const int col0 = u.pn * BM + wc * 32 + 8 * fq; asm volatile("" : "+v"(row0));
        const bf16* zp = Z + ZC_GATE + (size_t)(j - 1) * D + col0;
        v4u ga[2][2][2], gb[2][2][2];
#define MH_LOAD(buf, am_) do { const int ai_ = (am_) >> 1, m0_ = ((am_) & 1) * 2; _Pragma("unroll") for (int m = 0; m < 2; ++m) _Pragma("unroll") for (int bj = 0; bj < 2; ++bj) { \
            const bf16* q = zp + (size_t)(row0 + ai_ * HALF + (m0_ + m) * 16) * ZC + bj * HALF; ga[buf][m][bj] = *(const v4u*)q; gb[buf][m][bj] = *(const v4u*)(q + D); } } while (0)
#define MH_APPLY(buf, am_) do { const int ai_ = (am_) >> 1, m0_ = ((am_) & 1) * 2; _Pragma("unroll") for (int m = 0; m < 2; ++m) _Pragma("unroll") for (int bj = 0; bj < 2; ++bj) { float a[8], b[8]; unpack8(ga[buf][m][bj], a); unpack8(gb[buf][m][bj], b); \
            _Pragma("unroll") for (int i = 0; i < 8; ++i) { const float ea = __builtin_amdgcn_exp2f(fmaxf(a[i], -60.f) * -1.44269504f), eb = __builtin_amdgcn_exp2f(fmaxf(b[i], -60.f) * -1.44269504f); \
                acc[ai_][bj][m0_ + m][i >> 2][i & 3] *= (1.f + eb) * __builtin_amdgcn_rcpf(1.f + ea); } } } while (0)
        MH_LOAD(0, 0); MH_LOAD(1, 1); asm volatile("" ::: "memory");
        MH_APPLY(0, 0); asm volatile("" ::: "memory"); MH_LOAD(0, 2); asm volatile("" ::: "memory");
        MH_APPLY(1, 1); asm volatile("" ::: "memory"); MH_LOAD(1, 3); asm volatile("" ::: "memory");
        MH_APPLY(0, 2); asm volatile("" ::: "memory");
        MH_APPLY(1, 3); asm volatile("" ::: "memory");
#undef MH_LOAD
#undef MH_APPLY
    }
    __device__ __forceinline__ void operator()(const f32x4 (&acc)[2][2][4][2], const Unit& u, int wr, int wc, int fr, int fq) const {
        const int row0 = u.pm * BM + wr * 64 + fr, col0 = u.pn * BM + wc * 32 + 8 * fq;
#pragma unroll
        for (int ai = 0; ai < 2; ++ai) { v4u gg[4][2];
#pragma unroll
            for (int m = 0; m < 4; ++m)
#pragma unroll
                for (int bj = 0; bj < 2; ++bj) gg[m][bj] = *(const v4u*)(Z + (size_t)(row0 + ai * HALF + m * 16) * ZC + ZC_GATE + 3 * D + col0 + bj * HALF);
#pragma unroll
            for (int m = 0; m < 4; ++m)
#pragma unroll
                for (int bj = 0; bj < 2; ++bj) { const size_t row = (size_t)(row0 + ai * HALF + m * 16); const int col = col0 + bj * HALF; float gl[8]; unpack8(gg[m][bj], gl);
                    f32x4 v0 = acc[ai][bj][m][0], v1 = acc[ai][bj][m][1];
#pragma unroll
                    for (int j = 0; j < 4; ++j) { v0[j] *= sigmoidf_(gl[j]) * MGSC; v1[j] *= sigmoidf_(gl[4 + j]) * MGSC; }
                    unsigned w0 = 0, w1 = 0; w0 = __builtin_amdgcn_cvt_pk_fp8_f32(v0[0], v0[1], w0, false); w0 = __builtin_amdgcn_cvt_pk_fp8_f32(v0[2], v0[3], w0, true); w1 = __builtin_amdgcn_cvt_pk_fp8_f32(v1[0], v1[1], w1, false); w1 = __builtin_amdgcn_cvt_pk_fp8_f32(v1[2], v1[3], w1, true);
                    *(v2u*)((unsigned char*)msum + row * D + col) = (v2u){w0, w1}; }
            asm volatile("" ::: "memory"); }
    }
};
struct EpiResid {
    static constexpr bool PERM = true, AFTER_DRAIN = false; static constexpr int MID = 0;
    const void* X; bf16* Y; float sc; bool xbf;
    __device__ __forceinline__ void operator()(const f32x4 (&acc)[2][2][4][2], const Unit& u, int wr, int wc, int fr, int fq) const {
        const int row0 = u.pm * BM + wr * 64 + fr, col0 = u.pn * BM + wc * 32 + 8 * fq;
#pragma unroll
        for (int ai = 0; ai < 2; ++ai)
#pragma unroll
            for (int m = 0; m < 4; ++m) { const size_t off = (size_t)(row0 + ai * HALF + m * 16) * D + col0;
#pragma unroll
                for (int bj = 0; bj < 2; ++bj) { const f32x4 x0 = ld4(X, off + bj * HALF, xbf), x1 = ld4(X, off + bj * HALF + 4, xbf);
                    const f32x4 v0 = x0 * ALPHA + acc[ai][bj][m][0] * sc, v1 = x1 * ALPHA + acc[ai][bj][m][1] * sc;
                    u32x4 w; w.x = pk2(v0[0], v0[1]); w.y = pk2(v0[2], v0[3]); w.z = pk2(v1[0], v1[1]); w.w = pk2(v1[2], v1[3]); *(u32x4*)(Y + off + bj * HALF) = w; } }
    }
};
struct MoeTab {
    LAS int* t; LAS unsigned short* tok; LAS float* wt; LAS unsigned char* mte;
    __device__ __forceinline__ MoeTab(LAS unsigned char* lds) : t((LAS int*)(lds + TAB_OFF)), tok((LAS unsigned short*)(lds + TAB_OFF + 1024)), wt((LAS float*)(lds + TAB_OFF + 5120)), mte((LAS unsigned char*)(lds + TAB_OFF + 13312)) {}
};
__device__ __forceinline__ void moe_tables(const MoeTab& M, const unsigned* cnt  , int tid, int lane, int wave) {
    __syncthreads();
    if (wave == 0) { const int c = (int)cnt[64 * lane]; const int tiles = (c + 255) >> 8; const float incl = wave_scan_incl((float)tiles);
        M.t[80 + lane] = c; M.t[lane] = (int)incl - tiles; if (lane == 63) { M.t[64] = (int)incl; M.t[65] = (int)incl + T / 256; M.t[80 + 64] = T; } }
    __syncthreads();
    const int Mt = M.t[65];
    for (int mt = tid; mt < Mt; mt += 512) { int e = 0;
        for (int k = 1; k <= 64; ++k) e = (M.t[k] <= mt) ? k : e;
        M.mte[mt] = (unsigned char)e; }
    __syncthreads();
}
struct UpOrder {
    MoeTab M; int n;
    __device__ __forceinline__ bool next(int i, Unit& u) const { if (i >= n) return false; u.pm = M.t[168 + i]; u.pn = M.t[176 + i]; u.aux = i; return true; }
    __device__ __forceinline__ int row_token(int i, int r) const { return (int)M.tok[i * 256 + r]; }
    __device__ __forceinline__ void a_ready(const Unit&) const {}
    __device__ __forceinline__ void done(const Unit&) const {}
};
__device__ __forceinline__ int up_order_build(const MoeTab& M, const int* LIST, const float* WL, int wg, int G, int tid) {
    const int U = 4 * M.t[65];
    if (tid < 8) { const int L = tid * G + wg; if (L < U) { const int mt = L >> 2, q = L & 3, e = M.mte[mt]; M.t[168 + tid] = mt; M.t[176 + tid] = e * 4 + q; M.t[184 + tid] = e; M.t[192 + tid] = mt - M.t[e]; } }
    int n = 0;
#pragma unroll
    for (int i = 0; i < 8; ++i) n += (i * G + wg < U) ? 1 : 0;
    __syncthreads();
    for (int idx = tid; idx < n * 256; idx += 512) { const int i = idx >> 8, r = idx & 255, e = M.t[184 + i], li = M.t[192 + i] * 256 + r;
        int tk = 0; float w = 0.f;
        if (e < NE) { if (li < M.t[80 + e]) { tk = LIST[e * T + li]; w = WL[e * T + li]; } } else { tk = li; w = 1.f; }
        M.tok[idx] = (unsigned short)tk; M.wt[idx] = w; }
    __syncthreads();
    return n;
}
struct EpiGluSparse {
    static constexpr bool PERM = true, AFTER_DRAIN = false; static constexpr int MID = 0;
    LAS const float* wt; bf16* H;
    __device__ __forceinline__ void operator()(const f32x4 (&acc)[2][2][4][2], const Unit& u, int wr, int wc, int fr, int fq) const {
        const int q = u.pn & 3; const int rl0 = wr * 64 + fr, col0 = q * 128 + wc * 32 + 8 * fq;
#pragma unroll
        for (int ai = 0; ai < 2; ++ai)
#pragma unroll
            for (int m = 0; m < 4; ++m) { const int rl = rl0 + ai * HALF + m * 16; const float c = wt[u.aux * 256 + rl]; float h[8];
#pragma unroll
                for (int n = 0; n < 2; ++n)
#pragma unroll
                    for (int j = 0; j < 4; ++j) h[4 * n + j] = siluf_(acc[ai][0][m][n][j] * UPSC) * (acc[ai][1][m][n][j] * UPSC) * c;
#if MOE_DN_FP8
#pragma unroll
                for (int j = 0; j < 8; ++j) h[j] = __builtin_amdgcn_fmed3f(h[j] * HSC, -448.f, 448.f);
                unsigned w0 = 0, w1 = 0; w0 = __builtin_amdgcn_cvt_pk_fp8_f32(h[0], h[1], w0, false); w0 = __builtin_amdgcn_cvt_pk_fp8_f32(h[2], h[3], w0, true); w1 = __builtin_amdgcn_cvt_pk_fp8_f32(h[4], h[5], w1, false); w1 = __builtin_amdgcn_cvt_pk_fp8_f32(h[6], h[7], w1, true);
                *(v2u*)((unsigned char*)H + ((size_t)u.pm * 256 + rl) * ED + col0) = (v2u){w0, w1}; }
#else
                u32x4 w; w.x = pk2(h[0], h[1]); w.y = pk2(h[2], h[3]); w.z = pk2(h[4], h[5]); w.w = pk2(h[6], h[7]);
                *(u32x4*)(H + ((size_t)u.pm * 256 + rl) * ED + col0) = w; }
#endif
    }
};
struct DownOrder {
    MoeTab M; int G, c, U;
    __device__ __forceinline__ bool next(int i, Unit& u) const { const int L = i * G + c; if (L >= U) return false; const int mt = L >> 3, e = (int)M.mte[mt]; u.pm = mt; u.pn = e * 8 + (L & 7); const int left = M.t[80 + e] - 256 * (mt - M.t[e]); u.aux = left < 256 ? left : 256; return true; }
    __device__ __forceinline__ void a_ready(const Unit&) const {}
    __device__ __forceinline__ void done(const Unit&) const {}
};
struct EpiYexp {
    static constexpr bool PERM = true, AFTER_DRAIN = false; static constexpr int MID = 0;
    bf16* Y;
    __device__ __forceinline__ void operator()(const f32x4 (&acc)[2][2][4][2], const Unit& u, int wr, int wc, int fr, int fq) const {
        const int row0 = u.pm * BM + wr * 64 + fr, col0 = (u.pn & 7) * BM + wc * 32 + 8 * fq;
#pragma unroll
        for (int ai = 0; ai < 2; ++ai)
#pragma unroll
            for (int m = 0; m < 4; ++m) { bf16* rowp = Y + (size_t)(row0 + ai * HALF + m * 16) * D + col0;
                if (wr * 64 + fr + ai * HALF + m * 16 >= u.aux) continue;
#pragma unroll
                for (int bj = 0; bj < 2; ++bj) { const f32x4 v0 = acc[ai][bj][m][0] * DNSC, v1 = acc[ai][bj][m][1] * DNSC;
#if YEXP_FP8
                    *(v2u*)((unsigned char*)Y + (size_t)(row0 + ai * HALF + m * 16) * D + col0 + bj * HALF) = (v2u){pk4_f8(v0[0], v0[1], v0[2], v0[3], YSC), pk4_f8(v1[0], v1[1], v1[2], v1[3], YSC)}; } }
#else
                    u32x4 w; w.x = pk2(v0[0], v0[1]); w.y = pk2(v0[2], v0[3]); w.z = pk2(v1[0], v1[1]); w.w = pk2(v1[2], v1[3]); *(u32x4*)(rowp + bj * HALF) = w; } }
#endif
    }
};

struct TrItem { const float* src; bf16* dst; unsigned sld, dld; int f8; };
__device__ __forceinline__ void tr_load(const TrItem& t, int lane, v4f (&v)[8]) { const int r8 = lane >> 3, c4 = lane & 7;
#pragma unroll
    for (int i = 0; i < 8; ++i) v[i] = *(const v4f*)(t.src + (size_t)(8 * i + r8) * t.sld + 4 * c4); }
__device__ __forceinline__ void tr_store(const TrItem& t, const v4f (&v)[8], LAS float* scr, int lane, bool nostore = false) {
    { const int r8 = lane >> 3, c4 = lane & 7;
#pragma unroll
      for (int i = 0; i < 8; ++i) { LAS float* d = scr + (8 * i + r8) * 33 + 4 * c4; d[0] = v[i].x; d[1] = v[i].y; d[2] = v[i].z; d[3] = v[i].w; } }
    LDS_WAIT(); asm volatile("" ::: "memory");
    if (nostore) return;
    if (t.f8) {
        const int c = lane & 3;
#pragma unroll
        for (int j = 0; j < 2; ++j) { const int n = (lane >> 2) + 16 * j; const LAS float* s = scr + (16 * c) * 33 + n; unsigned w[4];
#pragma unroll
            for (int q = 0; q < 4; ++q) { unsigned x = 0; x = __builtin_amdgcn_cvt_pk_fp8_f32(s[(4 * q) * 33] * 64.f, s[(4 * q + 1) * 33] * 64.f, x, false); x = __builtin_amdgcn_cvt_pk_fp8_f32(s[(4 * q + 2) * 33] * 64.f, s[(4 * q + 3) * 33] * 64.f, x, true); w[q] = x; }
            *(v4u*)((unsigned char*)t.dst + (size_t)n * t.dld + 16 * c) = (v4u){w[0], w[1], w[2], w[3]}; }
    } else {
        const int c = lane & 7;
#pragma unroll
        for (int j = 0; j < 4; ++j) { const int n = (lane >> 3) + 8 * j; const LAS float* s = scr + (8 * c) * 33 + n;
            v4u o; o.x = pk2(s[0 * 33], s[1 * 33]); o.y = pk2(s[2 * 33], s[3 * 33]); o.z = pk2(s[4 * 33], s[5 * 33]); o.w = pk2(s[6 * 33], s[7 * 33]);
            *(v4u*)(t.dst + (size_t)n * t.dld + 8 * c) = o; }
    }
    LDS_WAIT(); asm volatile("" ::: "memory");
}
template <int PART> __device__ __forceinline__ TrItem tr_decode(const Params& p, int l, int it) {
    unsigned char* ws = p.ws;
    constexpr int N_IN = (ZC / 32) * (D / 64), N_BR = 4 * (BW / 64) * (D / 32), N_OUT = (D / 64) * (D / 32), N_UP = NEX * 2 * (D / 64) * (ED / 32);
    int r = it; TrItem t; t.f8 = 0;
    if (PART == 0) {
        const float* w_in = p.in[I_WIN] + (size_t)l * D * INC; const float* w_br = p.in[I_WBR] + (size_t)l * 4 * BW * D; const float* w_out = p.in[I_WOUT] + (size_t)l * D * D;
        bf16* WIN = (bf16*)(ws + WS_WIN); bf16* WBR = (bf16*)(ws + WS_WBR); bf16* WOUT = (bf16*)(ws + WS_WOUT);
        if (r < N_IN) { const int kb = r / (ZC / 32), n0 = (r % (ZC / 32)) * 32, k0 = kb * 64; const int sc = n0 + (n0 >= ZC_GATE ? 16 : (n0 >= ZC_MLQ ? 8 : 0));
            t.src = w_in + (size_t)k0 * INC + sc; t.sld = INC; t.dst = (bf16*)((unsigned char*)WIN + (size_t)n0 * D + k0); t.dld = D; t.f8 = 1; return t; } r -= N_IN;
        if (r < N_BR) { const int g = r / 512, rr = r % 512, k0 = (rr / 64) * 64, n0 = (rr % 64) * 32;
            t.src = w_br + ((size_t)g * BW + k0) * D + n0; t.sld = D;
#if MERGE_FP8
            t.dst = (bf16*)((unsigned char*)WBR + (size_t)n0 * BRW + g * BW + k0); t.dld = BRW; t.f8 = 1; return t; }
#else
            t.dst = WBR + (size_t)n0 * BRW + g * BW + k0; t.dld = BRW; return t; }
#endif
        r -= N_BR;
        { const int k0 = (r / 64) * 64, n0 = (r % 64) * 32; t.src = w_out + (size_t)k0 * D + n0; t.sld = D; t.dst = (bf16*)((unsigned char*)WOUT + (size_t)n0 * D + k0); t.dld = D; t.f8 = 1; return t; }
    } else {
        const float* w_g = p.in[I_WG] + (size_t)l * NE * D * ED; const float* w_u = p.in[I_WU] + (size_t)l * NE * D * ED; const float* w_d = p.in[I_WD] + (size_t)l * NE * ED * D;
        const float* s_g = p.in[I_SG] + (size_t)l * D * ED; const float* s_u = p.in[I_SU] + (size_t)l * D * ED; const float* s_d = p.in[I_SD] + (size_t)l * ED * D;
        bf16* WUP = (bf16*)(ws + WS_WUP); bf16* WDN = (bf16*)(ws + WS_WDN);
        if (r < N_UP) { const int e = r / 1024, rr = r % 1024, mat = rr / 512, r2 = rr % 512, k0 = (r2 / 16) * 64, n0 = (r2 % 16) * 32;
            const float* sb = (e < NE) ? ((mat ? w_u : w_g) + (size_t)e * D * ED) : (mat ? s_u : s_g);
            const int drow = e * 1024 + (n0 / 128) * 256 + mat * 128 + (n0 % 128);
            t.src = sb + (size_t)k0 * ED + n0; t.sld = ED;
#if MOE_UP_FP8
            t.dst = (bf16*)((unsigned char*)WUP + (size_t)drow * D + k0); t.dld = D; t.f8 = 1; return t; }
#else
            t.dst = WUP + (size_t)drow * D + k0; t.dld = D; return t; }
#endif
        r -= N_UP;
        { const int e = r / 512, rr = r % 512, k0 = (rr / 64) * 64, n0 = (rr % 64) * 32;
            const float* sb = (e < NE) ? (w_d + (size_t)e * ED * D) : s_d;
            t.src = sb + (size_t)k0 * D + n0; t.sld = D;
#if MOE_DN_FP8
            t.dst = (bf16*)((unsigned char*)WDN + ((size_t)e * D + n0) * ED + k0); t.dld = ED; t.f8 = 1; return t; }
#else
            t.dst = WDN + ((size_t)e * D + n0) * ED + k0; t.dld = ED; return t; }
#endif
    }
}
template <int PART> __device__ __forceinline__ void phase_convert(const Params& p, int l, LAS unsigned char* lds, int gw, int NGW, int wave, int lane, bool nostore = false, int lo = 0, int hi = 1 << 30) {
    constexpr int N_IN = (ZC / 32) * (D / 64), N_BR = 4 * (BW / 64) * (D / 32), N_OUT = (D / 64) * (D / 32), N_UP = NEX * 2 * (D / 64) * (ED / 32), N_DN = NEX * (ED / 64) * (D / 32);
    constexpr int NITEMS = (PART == 0) ? (N_IN + N_BR + N_OUT) : (N_UP + N_DN);
    LAS float* scr = (LAS float*)(lds + wave * 16384);
    const int NIT = hi < NITEMS ? hi : NITEMS;
    if (lo + gw >= NIT) return;
    TrItem cur = tr_decode<PART>(p, l, lo + gw); v4f va[8], vb[8];
    tr_load(cur, lane, va);
    for (int it = lo + gw; it < NIT; it += 2 * NGW) {
        const int i1 = it + NGW, i2 = it + 2 * NGW; TrItem nx = cur;
        if (i1 < NIT) { nx = tr_decode<PART>(p, l, i1); } tr_load(nx, lane, vb);
        tr_store(cur, va, scr, lane, nostore);
        if (i1 >= NIT) break;
        cur = nx; if (i2 < NIT) { cur = tr_decode<PART>(p, l, i2); } tr_load(cur, lane, va);
        tr_store(nx, vb, scr, lane, nostore);
        if (i2 >= NIT) break;
    }
}
__device__ __forceinline__ void phase_xprep(const Params& p, int l, const void* xin, bool xbf, LAS unsigned char* lds, int gw, int NGW, int tid, int lane) {
    const float* w_in = p.in[I_WIN] + (size_t)l * D * INC;
    constexpr int XP = 2052; LAS float* xt = (LAS float*)lds; LAS float* part = (LAS float*)lds;
    const int wave = tid >> 6, n_l = lane & 15, kq = lane >> 4, wg = gw >> 3, G = NGW >> 3;
    const int colw = n_l < 8 ? 4608 + n_l : 6152 + (n_l - 8);
    float bw[64];
#pragma unroll
    for (int q = 0; q < 64; ++q) bw[q] = w_in[(size_t)(256 * wave + 16 * (q >> 2) + 4 * kq + (q & 3)) * INC + colw];
    unsigned char* XB = p.ws + WS_XB; float* SMALL = (float*)(p.ws + WS_SMALL);
    __syncthreads();
    for (int tg = wg; tg < T / 16; tg += G) {
        {   v4f va[8], vb[8]; const size_t m0 = (size_t)tg * 16 + 2 * wave;
#pragma unroll
            for (int j = 0; j < 8; ++j) { va[j] = ld4(xin, m0 * D + 4 * lane + 256 * j, xbf); vb[j] = ld4(xin, (m0 + 1) * D + 4 * lane + 256 * j, xbf); }
#pragma unroll
            for (int rr = 0; rr < 2; ++rr) { unsigned* xo = (unsigned*)(XB + (m0 + rr) * D) + lane;
#pragma unroll
                for (int j = 0; j < 8; ++j) { const v4f v = rr ? vb[j] : va[j]; unsigned w = 0; w = __builtin_amdgcn_cvt_pk_fp8_f32(v.x, v.y, w, false); w = __builtin_amdgcn_cvt_pk_fp8_f32(v.z, v.w, w, true); xo[64 * j] = w;
                    *(LAS v4f*)(xt + (2 * wave + rr) * XP + 4 * lane + 256 * j) = v; } } }
        __syncthreads();
        {   pg8::f32x4 acc[4];
#pragma unroll
            for (int i = 0; i < 4; ++i) acc[i] = (pg8::f32x4){0.f, 0.f, 0.f, 0.f};
            const LAS float* xa = xt + n_l * XP + 256 * wave + 4 * kq;
#pragma unroll
            for (int s2 = 0; s2 < 16; ++s2) { const v4f a4 = *(const LAS v4f*)(xa + 16 * s2);
                acc[0] = __builtin_amdgcn_mfma_f32_16x16x4f32(a4.x, bw[4 * s2 + 0], acc[0], 0, 0, 0); acc[1] = __builtin_amdgcn_mfma_f32_16x16x4f32(a4.y, bw[4 * s2 + 1], acc[1], 0, 0, 0);
                acc[2] = __builtin_amdgcn_mfma_f32_16x16x4f32(a4.z, bw[4 * s2 + 2], acc[2], 0, 0, 0); acc[3] = __builtin_amdgcn_mfma_f32_16x16x4f32(a4.w, bw[4 * s2 + 3], acc[3], 0, 0, 0); }
            const pg8::f32x4 tot = (acc[0] + acc[1]) + (acc[2] + acc[3]);
            __syncthreads();
#pragma unroll
            for (int j = 0; j < 4; ++j) part[(wave * 16 + 4 * kq + j) * 16 + n_l] = tot[j]; }
        __syncthreads();
        if (tid < 256) { float a = 0.f;
#pragma unroll
            for (int w = 0; w < 8; ++w) a += part[w * 256 + tid];
            SMALL[(size_t)tg * 256 + tid] = a; }
        __syncthreads();
    }
}


typedef short bf16x8_t __attribute__((ext_vector_type(8)));
__device__ __forceinline__ void ml_pre_item(const Params& p, int l, LAS unsigned char* lds, int item, int tid, int wave, int lane) {
    const int h = item & 3, n = item >> 2; const size_t t0 = (size_t)n * 64;
    const bf16* Z = (const bf16*)(p.ws + WS_Z); const float* SMALL = (const float*)(p.ws + WS_SMALL);
    bf16* MQ = (bf16*)(p.ws + WS_MQ) + (size_t)item * 4096; bf16* MS = (bf16*)(p.ws + WS_MS) + (size_t)item * 4096; bf16* MK = (bf16*)(p.ws + WS_MK) + (size_t)item * 4096;
    bf16* MV = (bf16*)(p.ws + WS_MV) + (size_t)item * 9216; float* MFL = (float*)(p.ws + WS_MFL);
    LAS float* qs = (LAS float*)lds;
    LAS float* ks = qs + 64 * 65;
    LAS float* bs = ks + 64 * 65;
    LAS unsigned short* vs = (LAS unsigned short*)(bs + 128);
    { const int tk = tid >> 3, c8 = tid & 7; float f[8];
      unpack8(*(const v4u*)(Z + (t0 + tk) * ZC + ZC_MLQ + h * 64 + 8 * c8), f);
#pragma unroll
      for (int i = 0; i < 8; ++i) qs[tk * 65 + 8 * c8 + i] = f[i];
      unpack8(*(const v4u*)(Z + (t0 + tk) * ZC + ZC_MLK + h * 64 + 8 * c8), f);
#pragma unroll
      for (int i = 0; i < 8; ++i) ks[tk * 65 + 8 * c8 + i] = f[i]; }
#pragma unroll
    for (int r = 0; r < 2; ++r) { const int idx = tid + 512 * r, tk = idx >> 4, c8 = idx & 15;
        *(LAS v4u*)(vs + tk * 136 + 8 * c8) = *(const v4u*)(Z + (t0 + tk) * ZC + ZC_MLV + h * 128 + 8 * c8); }
    if (wave == 0) { const float fp = SMALL[(t0 + lane) * 16 + 12 + h] + p.in[I_MLFB][l * 4 + h]; const float lf = -softplusf_(-fp);
        bs[lane] = wave_scan_incl(lf); bs[64 + lane] = SMALL[(t0 + lane) * 16 + 8 + h] + p.in[I_MLIB][l * 4 + h]; }
    __syncthreads();
    const float blast = bs[63];
    { const int i = tid >> 3, jb = tid & 7; const float bi = bs[i];
      { const float e = __expf(bi) * 0.125f; float o[8];
#pragma unroll
        for (int x = 0; x < 8; ++x) o[x] = qs[i * 65 + 8 * jb + x] * e;
        v4u w; w.x = pk2(o[0], o[1]); w.y = pk2(o[2], o[3]); w.z = pk2(o[4], o[5]); w.w = pk2(o[6], o[7]); *(v4u*)(MQ + i * 64 + 8 * jb) = w; }
      {
          const int ti = wave >> 1, c16 = lane & 15, g4 = lane >> 4, i2 = 16 * ti + c16; const float bi2 = bs[i2];
#define ML_F8(dst, base) do { const LAS float* _b = (base); const v4u _w = (v4u){pg8::cvt_pk_bf16(_b[0], _b[1]), pg8::cvt_pk_bf16(_b[2], _b[3]), pg8::cvt_pk_bf16(_b[4], _b[5]), pg8::cvt_pk_bf16(_b[6], _b[7])}; dst = __builtin_bit_cast(bf16x8_t, _w); } while (0)
          bf16x8_t bq[2];
#pragma unroll
          for (int s2 = 0; s2 < 2; ++s2) ML_F8(bq[s2], qs + i2 * 65 + 32 * s2 + 8 * g4);
#pragma unroll
          for (int jj = 0; jj < 2; ++jj) { const int tj = 2 * (wave & 1) + jj; v2u sw = (v2u){0u, 0u};
              if (tj <= ti) { pg8::f32x4 d = {0.f, 0.f, 0.f, 0.f};
#pragma unroll
                  for (int s2 = 0; s2 < 2; ++s2) { bf16x8_t a; ML_F8(a, ks + (16 * tj + c16) * 65 + 32 * s2 + 8 * g4); d = __builtin_amdgcn_mfma_f32_16x16x32_bf16(a, bq[s2], d, 0, 0, 0); }
                  float v4[4];
#pragma unroll
                  for (int r = 0; r < 4; ++r) { const int j = 16 * tj + 4 * g4 + r; v4[r] = (j <= i2) ? __expf(bi2 - bs[j] + bs[64 + j]) * d[r] * 0.125f : 0.f; }
                  sw = (v2u){pk2(v4[0], v4[1]), pk2(v4[2], v4[3])}; }
              *(v2u*)(MS + i2 * 64 + 16 * tj + 4 * g4) = sw; }
#undef ML_F8
      }
      { float o[8];
#pragma unroll
        for (int x = 0; x < 8; ++x) { const int j = 8 * jb + x; o[x] = ks[j * 65 + i] * __expf(blast - bs[j] + bs[64 + j]); }
        v4u w; w.x = pk2(o[0], o[1]); w.y = pk2(o[2], o[3]); w.z = pk2(o[4], o[5]); w.w = pk2(o[6], o[7]); *(v4u*)(MK + i * 64 + 8 * jb) = w; }
    }
    { const int c = tid >> 2, jq = tid & 3; unsigned w[8];
#pragma unroll
      for (int x = 0; x < 8; ++x) w[x] = (unsigned)vs[(16 * jq + 2 * x) * 136 + c] | ((unsigned)vs[(16 * jq + 2 * x + 1) * 136 + c] << 16);
      *(v4u*)(MV + c * 64 + 16 * jq) = (v4u){w[0], w[1], w[2], w[3]}; *(v4u*)(MV + c * 64 + 16 * jq + 8) = (v4u){w[4], w[5], w[6], w[7]};
      if (tid < 64) { const int c2 = 128 + (tid >> 2); const unsigned one = (c2 == 128) ? 0x3F803F80u : 0u;
          *(v4u*)(MV + c2 * 64 + 16 * jq) = (v4u){one, one, one, one}; *(v4u*)(MV + c2 * 64 + 16 * jq + 8) = (v4u){one, one, one, one}; } }
    if (tid == 0) MFL[item] = __expf(blast);
    __syncthreads();
}
struct MlFrags { bf16x8_t q[2], s[2], kt[2], vt[2]; float fl; };
__device__ __forceinline__ void ml_load(MlFrags& F, const Params& p, int item, int offA, int offV) {
    const bf16* MQ = (const bf16*)(p.ws + WS_MQ) + (size_t)item * 4096; const bf16* MS = (const bf16*)(p.ws + WS_MS) + (size_t)item * 4096; const bf16* MK = (const bf16*)(p.ws + WS_MK) + (size_t)item * 4096;
    const bf16* MV = (const bf16*)(p.ws + WS_MV) + (size_t)item * 9216;
#pragma unroll
    for (int ks = 0; ks < 2; ++ks) { F.q[ks] = *(const bf16x8_t*)(MQ + offA + 32 * ks); F.s[ks] = *(const bf16x8_t*)(MS + offA + 32 * ks); F.kt[ks] = *(const bf16x8_t*)(MK + offA + 32 * ks); F.vt[ks] = *(const bf16x8_t*)(MV + offV + 32 * ks); }
    F.fl = ((const float*)(p.ws + WS_MFL))[item];
}
__device__ __forceinline__ void ml_seq(const Params& p, LAS unsigned char* lds, int wgi, int wave, int lane) {
    const int u = wgi * 2 + (wave >> 2), wi = wave & 3, h = u / 9, sl = u % 9, g = lane >> 4, c = lane & 15;
    LAS unsigned short* CT = (LAS unsigned short*)(lds + (wave >> 2) * 4096);
    float* HO = (float*)(p.ws + WS_HO); float* HDEN = (float*)(p.ws + WS_HDEN);
    const int offA = (16 * wi + c) * 64 + 8 * g, offV = (16 * sl + c) * 64 + 8 * g;
    *(LAS v2u*)(CT + c * 64 + 16 * wi + 4 * g) = (v2u){0u, 0u};
    pg8::f32x4 Cacc = {0.f, 0.f, 0.f, 0.f};
    __syncthreads();
    MlFrags F0, F1;
    ml_load(F0, p, h, offA, offV);
#define ML_STEP(F, n_) do { const int cur = (n_) & 1; \
        const bf16x8_t c0 = *(const LAS bf16x8_t*)(CT + cur * 1024 + c * 64 + 8 * g), c1 = *(const LAS bf16x8_t*)(CT + cur * 1024 + c * 64 + 32 + 8 * g); \
        pg8::f32x4 num = {0.f, 0.f, 0.f, 0.f}; \
        num = __builtin_amdgcn_mfma_f32_16x16x32_bf16(F.q[0], c0, num, 0, 0, 0); num = __builtin_amdgcn_mfma_f32_16x16x32_bf16(F.q[1], c1, num, 0, 0, 0); \
        num = __builtin_amdgcn_mfma_f32_16x16x32_bf16(F.s[0], F.vt[0], num, 0, 0, 0); num = __builtin_amdgcn_mfma_f32_16x16x32_bf16(F.s[1], F.vt[1], num, 0, 0, 0); \
        Cacc = Cacc * F.fl; \
        Cacc = __builtin_amdgcn_mfma_f32_16x16x32_bf16(F.kt[0], F.vt[0], Cacc, 0, 0, 0); Cacc = __builtin_amdgcn_mfma_f32_16x16x32_bf16(F.kt[1], F.vt[1], Cacc, 0, 0, 0); \
        { v2u w; w.x = pk2(Cacc[0], Cacc[1]); w.y = pk2(Cacc[2], Cacc[3]); *(LAS v2u*)(CT + (cur ^ 1) * 1024 + c * 64 + 16 * wi + 4 * g) = w; } \
        { const size_t tb = (size_t)(n_) * 64 + 16 * wi + 4 * g; \
          if (sl < 8) { _Pragma("unroll") for (int r = 0; r < 4; ++r) HO[(tb + r) * BW + h * 128 + 16 * sl + c] = num[r]; } \
          else if (c == 0) { _Pragma("unroll") for (int r = 0; r < 4; ++r) HDEN[(tb + r) * 4 + h] = num[r]; } } \
        LDS_BAR(); } while (0)
    for (int n = 0; n < T / 64; n += 2) {
        ml_load(F1, p, (n + 1) * 4 + h, offA, offV);
        ML_STEP(F0, n);
        ml_load(F0, p, ((n + 2 < T / 64) ? n + 2 : n) * 4 + h, offA, offV);
        ML_STEP(F1, n + 1);
    }
#undef ML_STEP
}


constexpr int QP = 132;
__device__ __forceinline__ void gdn_pre_item(const Params& p, int l, LAS unsigned char* lds, int item, int tid, int wave, int lane) {
    const int h = item & 3, n = item >> 2; const size_t t0 = (size_t)n * 64;
    const bf16* Z = (const bf16*)(p.ws + WS_Z); const float* SMALL = (const float*)(p.ws + WS_SMALL);
    float* GU = (float*)(p.ws + WS_GU) + (size_t)item * 8192; bf16* GNW = (bf16*)(p.ws + WS_GNW) + (size_t)item * 8192; bf16* GQG = (bf16*)(p.ws + WS_GQG) + (size_t)item * 8192;
    bf16* GAT = (bf16*)(p.ws + WS_GAT) + (size_t)item * 4096; bf16* GKT = (bf16*)(p.ws + WS_GKT) + (size_t)item * 8192; float* GDL = (float*)(p.ws + WS_GDL);
    const float* cw = p.in[I_CONVW] + (size_t)l * 4 * 1536;
    LAS float* qs = (LAS float*)lds; LAS float* ks = qs + 64 * QP; LAS float* vs = ks + 64 * QP; LAS float* Ls = vs + 64 * QP;   LAS float* gcs = Ls + 64 * 68; LAS float* bts = gcs + 64; LAS float* btg = bts + 64;
    LAS unsigned short* zq = (LAS unsigned short*)(lds + 131584); LAS unsigned short* zk = (LAS unsigned short*)Ls; LAS unsigned short* zv = (LAS unsigned short*)vs; LAS float* cwl = btg + 64;
    float gate_b = 0.f, gate_a = 0.f; if (wave == 0) { gate_b = SMALL[(t0 + lane) * 16 + h]; gate_a = SMALL[(t0 + lane) * 16 + 4 + h]; }
    {   v4u zr[7]; v4f wr4 = (v4f){0.f, 0.f, 0.f, 0.f};
#pragma unroll
        for (int q = 0; q < 7; ++q) { const int idx = tid + 512 * q; zr[q] = (v4u){0u, 0u, 0u, 0u};
            if (idx < 3216) { const int seg = idx / 1072, rem = idx % 1072, r = rem >> 4, c16 = rem & 15; const long tt = (long)t0 - 3 + r;
                if (tt >= 0) zr[q] = *(const v4u*)(Z + (size_t)tt * ZC + ZC_GDN + seg * 512 + h * 128 + 8 * c16); } }
        if (tid < 384) { const int j = tid / 96, rest = tid % 96, i = rest >> 5, c4 = rest & 31; wr4 = *(const v4f*)(cw + j * 1536 + i * 512 + h * 128 + 4 * c4); }
#pragma unroll
        for (int q = 0; q < 7; ++q) { const int idx = tid + 512 * q;
            if (idx < 3216) { const int seg = idx / 1072, rem = idx % 1072; LAS unsigned short* zb = seg == 0 ? zq : (seg == 1 ? zk : zv); *(LAS v4u*)(zb + 8 * rem) = zr[q]; } }
        if (tid < 384) *(LAS v4f*)(cwl + 4 * tid) = wr4;
    }
    __syncthreads();
    { const int tk = tid >> 3, part = tid & 7; float av[16];
#pragma unroll 1
      for (int i = 0; i < 3; ++i) { float a[16]; const LAS unsigned short* zb = i == 0 ? zq : (i == 1 ? zk : zv);
#pragma unroll
        for (int x = 0; x < 16; ++x) a[x] = 0.f;
#pragma unroll
        for (int j = 0; j < 4; ++j) { const LAS unsigned short* src = zb + (tk + j) * 128 + 16 * part; float x0[8], x1[8]; unpack8(*(const LAS v4u*)src, x0); unpack8(*(const LAS v4u*)(src + 8), x1);
            const LAS float* wp = cwl + (j * 3 + i) * 128 + 16 * part;
#pragma unroll
            for (int x4 = 0; x4 < 2; ++x4) { const v4f w0 = *(const LAS v4f*)(wp + 4 * x4), w1 = *(const LAS v4f*)(wp + 8 + 4 * x4);
                a[4 * x4] += w0.x * x0[4 * x4]; a[4 * x4 + 1] += w0.y * x0[4 * x4 + 1]; a[4 * x4 + 2] += w0.z * x0[4 * x4 + 2]; a[4 * x4 + 3] += w0.w * x0[4 * x4 + 3];
                a[8 + 4 * x4] += w1.x * x1[4 * x4]; a[8 + 4 * x4 + 1] += w1.y * x1[4 * x4 + 1]; a[8 + 4 * x4 + 2] += w1.z * x1[4 * x4 + 2]; a[8 + 4 * x4 + 3] += w1.w * x1[4 * x4 + 3]; } }
        float ss = 0.f;
#pragma unroll
        for (int x = 0; x < 16; ++x) { a[x] = siluf_(a[x]); ss += a[x] * a[x]; }
        if (i < 2) { ss = sum8(ss); const float r = rsqrtf(ss + 1e-6f) * (i == 0 ? 0.08838834764831845f : 1.f);
#pragma unroll
            for (int x = 0; x < 16; ++x) a[x] *= r;
            LAS float* dst = (i == 0 ? qs : ks) + tk * QP + 16 * part;
#pragma unroll
            for (int x4 = 0; x4 < 4; ++x4) *(LAS v4f*)(dst + 4 * x4) = (v4f){a[4 * x4], a[4 * x4 + 1], a[4 * x4 + 2], a[4 * x4 + 3]}; }
        else {
#pragma unroll
            for (int x = 0; x < 16; ++x) av[x] = a[x]; } }
      __syncthreads();
      { LAS float* dst = vs + tk * QP + 16 * part;
#pragma unroll
        for (int x4 = 0; x4 < 4; ++x4) *(LAS v4f*)(dst + 4 * x4) = (v4f){av[4 * x4], av[4 * x4 + 1], av[4 * x4 + 2], av[4 * x4 + 3]}; } }
    if (wave == 0) { const float bb = gate_b, aa = gate_a;
        const float g = -__expf(p.in[I_ALOG][l * 4 + h]) * softplusf_(aa + p.in[I_DTB][l * 4 + h]);
        const float gc = wave_scan_incl(g), bt = sigmoidf_(bb); gcs[lane] = gc; bts[lane] = bt; btg[lane] = bt * __expf(gc); }
    __syncthreads();
    { const int ti = wave >> 1, c16 = lane & 15, g4 = lane >> 4, i = 16 * ti + c16; const float gi = gcs[i], bi = bts[i];
#define GDN_F8(dst, base) do { const v4f _a = *(const LAS v4f*)(base), _b = *(const LAS v4f*)((base) + 4); const v4u _w = (v4u){pg8::cvt_pk_bf16(_a.x, _a.y), pg8::cvt_pk_bf16(_a.z, _a.w), pg8::cvt_pk_bf16(_b.x, _b.y), pg8::cvt_pk_bf16(_b.z, _b.w)}; dst = __builtin_bit_cast(bf16x8_t, _w); } while (0)
      bf16x8_t bk[4], bq[4];
#pragma unroll
      for (int s4 = 0; s4 < 4; ++s4) { GDN_F8(bk[s4], ks + i * QP + 32 * s4 + 8 * g4); GDN_F8(bq[s4], qs + i * QP + 32 * s4 + 8 * g4); }
#pragma unroll
      for (int jj = 0; jj < 2; ++jj) { const int tj = 2 * (wave & 1) + jj; v4f lv = (v4f){0.f, 0.f, 0.f, 0.f}; v2u aw = (v2u){0u, 0u};
          if (tj <= ti) { pg8::f32x4 dk = {0.f, 0.f, 0.f, 0.f}, dq = {0.f, 0.f, 0.f, 0.f};
#pragma unroll
              for (int s4 = 0; s4 < 4; ++s4) { bf16x8_t a; GDN_F8(a, ks + (16 * tj + c16) * QP + 32 * s4 + 8 * g4);
                  dk = __builtin_amdgcn_mfma_f32_16x16x32_bf16(a, bk[s4], dk, 0, 0, 0); dq = __builtin_amdgcn_mfma_f32_16x16x32_bf16(a, bq[s4], dq, 0, 0, 0); }
              float l4[4], a4[4];
#pragma unroll
              for (int r = 0; r < 4; ++r) { const int j = 16 * tj + 4 * g4 + r; const float dc = __expf(gi - gcs[j]); l4[r] = (j < i) ? bi * dk[r] * dc : 0.f; a4[r] = (j <= i) ? dq[r] * dc : 0.f; }
              lv = (v4f){l4[0], l4[1], l4[2], l4[3]}; aw = (v2u){pk2(a4[0], a4[1]), pk2(a4[2], a4[3])}; }
          *(LAS v4f*)(Ls + i * 68 + 16 * tj + 4 * g4) = lv; *(v2u*)(GAT + i * 64 + 16 * tj + 4 * g4) = aw; }
#undef GDN_F8
    }
    __syncthreads();
    if (tid < 256) {
        const int c = tid; int vz; asm volatile("v_mov_b32 %0, 0" : "=v"(vz));
        const LAS float* rp = (c < 128) ? (vs + c) : (ks + (c - 128)); const LAS float* mp = ((c < 128) ? bts : btg) + vz;
#define GDN_RHS(i) (rp[(i) * QP] * mp[(i)])
#define GDN_L4(i, j4) (*(const LAS v4f*)(Ls + (i) * 68 + 4 * (j4) + vz))
        float x0 = GDN_RHS(0); __builtin_amdgcn_sched_barrier(0);
        float x1 = GDN_RHS(1); { const v4f l0 = GDN_L4(1, 0); __builtin_amdgcn_sched_barrier(0); x1 -= l0.x * x0; } __builtin_amdgcn_sched_barrier(0);
        float x2 = GDN_RHS(2); { const v4f l0 = GDN_L4(2, 0); __builtin_amdgcn_sched_barrier(0); x2 -= l0.x * x0; x2 -= l0.y * x1; } __builtin_amdgcn_sched_barrier(0);
        float x3 = GDN_RHS(3); { const v4f l0 = GDN_L4(3, 0); __builtin_amdgcn_sched_barrier(0); x3 -= l0.x * x0; x3 -= l0.y * x1; x3 -= l0.z * x2; } __builtin_amdgcn_sched_barrier(0);
        float x4 = GDN_RHS(4); { const v4f l0 = GDN_L4(4, 0); __builtin_amdgcn_sched_barrier(0); x4 -= l0.x * x0; x4 -= l0.y * x1; x4 -= l0.z * x2; x4 -= l0.w * x3; } __builtin_amdgcn_sched_barrier(0);
        float x5 = GDN_RHS(5); { const v4f l0 = GDN_L4(5, 0); const v4f l1 = GDN_L4(5, 1); __builtin_amdgcn_sched_barrier(0); x5 -= l0.x * x0; x5 -= l0.y * x1; x5 -= l0.z * x2; x5 -= l0.w * x3; x5 -= l1.x * x4; } __builtin_amdgcn_sched_barrier(0);
        float x6 = GDN_RHS(6); { const v4f l0 = GDN_L4(6, 0); const v4f l1 = GDN_L4(6, 1); __builtin_amdgcn_sched_barrier(0); x6 -= l0.x * x0; x6 -= l0.y * x1; x6 -= l0.z * x2; x6 -= l0.w * x3; x6 -= l1.x * x4; x6 -= l1.y * x5; } __builtin_amdgcn_sched_barrier(0);
        float x7 = GDN_RHS(7); { const v4f l0 = GDN_L4(7, 0); const v4f l1 = GDN_L4(7, 1); __builtin_amdgcn_sched_barrier(0); x7 -= l0.x * x0; x7 -= l0.y * x1; x7 -= l0.z * x2; x7 -= l0.w * x3; x7 -= l1.x * x4; x7 -= l1.y * x5; x7 -= l1.z * x6; } __builtin_amdgcn_sched_barrier(0);
        float x8 = GDN_RHS(8); { const v4f l0 = GDN_L4(8, 0); const v4f l1 = GDN_L4(8, 1); __builtin_amdgcn_sched_barrier(0); x8 -= l0.x * x0; x8 -= l0.y * x1; x8 -= l0.z * x2; x8 -= l0.w * x3; x8 -= l1.x * x4; x8 -= l1.y * x5; x8 -= l1.z * x6; x8 -= l1.w * x7; } __builtin_amdgcn_sched_barrier(0);
        float x9 = GDN_RHS(9); { const v4f l0 = GDN_L4(9, 0); const v4f l1 = GDN_L4(9, 1); const v4f l2 = GDN_L4(9, 2); __builtin_amdgcn_sched_barrier(0); x9 -= l0.x * x0; x9 -= l0.y * x1; x9 -= l0.z * x2; x9 -= l0.w * x3; x9 -= l1.x * x4; x9 -= l1.y * x5; x9 -= l1.z * x6; x9 -= l1.w * x7; x9 -= l2.x * x8; } __builtin_amdgcn_sched_barrier(0);
        float x10 = GDN_RHS(10); { const v4f l0 = GDN_L4(10, 0); const v4f l1 = GDN_L4(10, 1); const v4f l2 = GDN_L4(10, 2); __builtin_amdgcn_sched_barrier(0); x10 -= l0.x * x0; x10 -= l0.y * x1; x10 -= l0.z * x2; x10 -= l0.w * x3; x10 -= l1.x * x4; x10 -= l1.y * x5; x10 -= l1.z * x6; x10 -= l1.w * x7; x10 -= l2.x * x8; x10 -= l2.y * x9; } __builtin_amdgcn_sched_barrier(0);
        float x11 = GDN_RHS(11); { const v4f l0 = GDN_L4(11, 0); const v4f l1 = GDN_L4(11, 1); const v4f l2 = GDN_L4(11, 2); __builtin_amdgcn_sched_barrier(0); x11 -= l0.x * x0; x11 -= l0.y * x1; x11 -= l0.z * x2; x11 -= l0.w * x3; x11 -= l1.x * x4; x11 -= l1.y * x5; x11 -= l1.z * x6; x11 -= l1.w * x7; x11 -= l2.x * x8; x11 -= l2.y * x9; x11 -= l2.z * x10; } __builtin_amdgcn_sched_barrier(0);
        float x12 = GDN_RHS(12); { const v4f l0 = GDN_L4(12, 0); const v4f l1 = GDN_L4(12, 1); const v4f l2 = GDN_L4(12, 2); __builtin_amdgcn_sched_barrier(0); x12 -= l0.x * x0; x12 -= l0.y * x1; x12 -= l0.z * x2; x12 -= l0.w * x3; x12 -= l1.x * x4; x12 -= l1.y * x5; x12 -= l1.z * x6; x12 -= l1.w * x7; x12 -= l2.x * x8; x12 -= l2.y * x9; x12 -= l2.z * x10; x12 -= l2.w * x11; } __builtin_amdgcn_sched_barrier(0);
        float x13 = GDN_RHS(13); { const v4f l0 = GDN_L4(13, 0); const v4f l1 = GDN_L4(13, 1); const v4f l2 = GDN_L4(13, 2); const v4f l3 = GDN_L4(13, 3); __builtin_amdgcn_sched_barrier(0); x13 -= l0.x * x0; x13 -= l0.y * x1; x13 -= l0.z * x2; x13 -= l0.w * x3; x13 -= l1.x * x4; x13 -= l1.y * x5; x13 -= l1.z * x6; x13 -= l1.w * x7; x13 -= l2.x * x8; x13 -= l2.y * x9; x13 -= l2.z * x10; x13 -= l2.w * x11; x13 -= l3.x * x12; } __builtin_amdgcn_sched_barrier(0);
        float x14 = GDN_RHS(14); { const v4f l0 = GDN_L4(14, 0); const v4f l1 = GDN_L4(14, 1); const v4f l2 = GDN_L4(14, 2); const v4f l3 = GDN_L4(14, 3); __builtin_amdgcn_sched_barrier(0); x14 -= l0.x * x0; x14 -= l0.y * x1; x14 -= l0.z * x2; x14 -= l0.w * x3; x14 -= l1.x * x4; x14 -= l1.y * x5; x14 -= l1.z * x6; x14 -= l1.w * x7; x14 -= l2.x * x8; x14 -= l2.y * x9; x14 -= l2.z * x10; x14 -= l2.w * x11; x14 -= l3.x * x12; x14 -= l3.y * x13; } __builtin_amdgcn_sched_barrier(0);
        float x15 = GDN_RHS(15); { const v4f l0 = GDN_L4(15, 0); const v4f l1 = GDN_L4(15, 1); const v4f l2 = GDN_L4(15, 2); const v4f l3 = GDN_L4(15, 3); __builtin_amdgcn_sched_barrier(0); x15 -= l0.x * x0; x15 -= l0.y * x1; x15 -= l0.z * x2; x15 -= l0.w * x3; x15 -= l1.x * x4; x15 -= l1.y * x5; x15 -= l1.z * x6; x15 -= l1.w * x7; x15 -= l2.x * x8; x15 -= l2.y * x9; x15 -= l2.z * x10; x15 -= l2.w * x11; x15 -= l3.x * x12; x15 -= l3.y * x13; x15 -= l3.z * x14; } __builtin_amdgcn_sched_barrier(0);
        float x16 = GDN_RHS(16); { const v4f l0 = GDN_L4(16, 0); const v4f l1 = GDN_L4(16, 1); const v4f l2 = GDN_L4(16, 2); const v4f l3 = GDN_L4(16, 3); __builtin_amdgcn_sched_barrier(0); x16 -= l0.x * x0; x16 -= l0.y * x1; x16 -= l0.z * x2; x16 -= l0.w * x3; x16 -= l1.x * x4; x16 -= l1.y * x5; x16 -= l1.z * x6; x16 -= l1.w * x7; x16 -= l2.x * x8; x16 -= l2.y * x9; x16 -= l2.z * x10; x16 -= l2.w * x11; x16 -= l3.x * x12; x16 -= l3.y * x13; x16 -= l3.z * x14; x16 -= l3.w * x15; } __builtin_amdgcn_sched_barrier(0);
        float x17 = GDN_RHS(17); { const v4f l0 = GDN_L4(17, 0); const v4f l1 = GDN_L4(17, 1); const v4f l2 = GDN_L4(17, 2); const v4f l3 = GDN_L4(17, 3); const v4f l4 = GDN_L4(17, 4); __builtin_amdgcn_sched_barrier(0); x17 -= l0.x * x0; x17 -= l0.y * x1; x17 -= l0.z * x2; x17 -= l0.w * x3; x17 -= l1.x * x4; x17 -= l1.y * x5; x17 -= l1.z * x6; x17 -= l1.w * x7; x17 -= l2.x * x8; x17 -= l2.y * x9; x17 -= l2.z * x10; x17 -= l2.w * x11; x17 -= l3.x * x12; x17 -= l3.y * x13; x17 -= l3.z * x14; x17 -= l3.w * x15; x17 -= l4.x * x16; } __builtin_amdgcn_sched_barrier(0);
        float x18 = GDN_RHS(18); { const v4f l0 = GDN_L4(18, 0); const v4f l1 = GDN_L4(18, 1); const v4f l2 = GDN_L4(18, 2); const v4f l3 = GDN_L4(18, 3); const v4f l4 = GDN_L4(18, 4); __builtin_amdgcn_sched_barrier(0); x18 -= l0.x * x0; x18 -= l0.y * x1; x18 -= l0.z * x2; x18 -= l0.w * x3; x18 -= l1.x * x4; x18 -= l1.y * x5; x18 -= l1.z * x6; x18 -= l1.w * x7; x18 -= l2.x * x8; x18 -= l2.y * x9; x18 -= l2.z * x10; x18 -= l2.w * x11; x18 -= l3.x * x12; x18 -= l3.y * x13; x18 -= l3.z * x14; x18 -= l3.w * x15; x18 -= l4.x * x16; x18 -= l4.y * x17; } __builtin_amdgcn_sched_barrier(0);
        float x19 = GDN_RHS(19); { const v4f l0 = GDN_L4(19, 0); const v4f l1 = GDN_L4(19, 1); const v4f l2 = GDN_L4(19, 2); const v4f l3 = GDN_L4(19, 3); const v4f l4 = GDN_L4(19, 4); __builtin_amdgcn_sched_barrier(0); x19 -= l0.x * x0; x19 -= l0.y * x1; x19 -= l0.z * x2; x19 -= l0.w * x3; x19 -= l1.x * x4; x19 -= l1.y * x5; x19 -= l1.z * x6; x19 -= l1.w * x7; x19 -= l2.x * x8; x19 -= l2.y * x9; x19 -= l2.z * x10; x19 -= l2.w * x11; x19 -= l3.x * x12; x19 -= l3.y * x13; x19 -= l3.z * x14; x19 -= l3.w * x15; x19 -= l4.x * x16; x19 -= l4.y * x17; x19 -= l4.z * x18; } __builtin_amdgcn_sched_barrier(0);
        float x20 = GDN_RHS(20); { const v4f l0 = GDN_L4(20, 0); const v4f l1 = GDN_L4(20, 1); const v4f l2 = GDN_L4(20, 2); const v4f l3 = GDN_L4(20, 3); const v4f l4 = GDN_L4(20, 4); __builtin_amdgcn_sched_barrier(0); x20 -= l0.x * x0; x20 -= l0.y * x1; x20 -= l0.z * x2; x20 -= l0.w * x3; x20 -= l1.x * x4; x20 -= l1.y * x5; x20 -= l1.z * x6; x20 -= l1.w * x7; x20 -= l2.x * x8; x20 -= l2.y * x9; x20 -= l2.z * x10; x20 -= l2.w * x11; x20 -= l3.x * x12; x20 -= l3.y * x13; x20 -= l3.z * x14; x20 -= l3.w * x15; x20 -= l4.x * x16; x20 -= l4.y * x17; x20 -= l4.z * x18; x20 -= l4.w * x19; } __builtin_amdgcn_sched_barrier(0);
        float x21 = GDN_RHS(21); { const v4f l0 = GDN_L4(21, 0); const v4f l1 = GDN_L4(21, 1); const v4f l2 = GDN_L4(21, 2); const v4f l3 = GDN_L4(21, 3); const v4f l4 = GDN_L4(21, 4); const v4f l5 = GDN_L4(21, 5); __builtin_amdgcn_sched_barrier(0); x21 -= l0.x * x0; x21 -= l0.y * x1; x21 -= l0.z * x2; x21 -= l0.w * x3; x21 -= l1.x * x4; x21 -= l1.y * x5; x21 -= l1.z * x6; x21 -= l1.w * x7; x21 -= l2.x * x8; x21 -= l2.y * x9; x21 -= l2.z * x10; x21 -= l2.w * x11; x21 -= l3.x * x12; x21 -= l3.y * x13; x21 -= l3.z * x14; x21 -= l3.w * x15; x21 -= l4.x * x16; x21 -= l4.y * x17; x21 -= l4.z * x18; x21 -= l4.w * x19; x21 -= l5.x * x20; } __builtin_amdgcn_sched_barrier(0);
        float x22 = GDN_RHS(22); { const v4f l0 = GDN_L4(22, 0); const v4f l1 = GDN_L4(22, 1); const v4f l2 = GDN_L4(22, 2); const v4f l3 = GDN_L4(22, 3); const v4f l4 = GDN_L4(22, 4); const v4f l5 = GDN_L4(22, 5); __builtin_amdgcn_sched_barrier(0); x22 -= l0.x * x0; x22 -= l0.y * x1; x22 -= l0.z * x2; x22 -= l0.w * x3; x22 -= l1.x * x4; x22 -= l1.y * x5; x22 -= l1.z * x6; x22 -= l1.w * x7; x22 -= l2.x * x8; x22 -= l2.y * x9; x22 -= l2.z * x10; x22 -= l2.w * x11; x22 -= l3.x * x12; x22 -= l3.y * x13; x22 -= l3.z * x14; x22 -= l3.w * x15; x22 -= l4.x * x16; x22 -= l4.y * x17; x22 -= l4.z * x18; x22 -= l4.w * x19; x22 -= l5.x * x20; x22 -= l5.y * x21; } __builtin_amdgcn_sched_barrier(0);
        float x23 = GDN_RHS(23); { const v4f l0 = GDN_L4(23, 0); const v4f l1 = GDN_L4(23, 1); const v4f l2 = GDN_L4(23, 2); const v4f l3 = GDN_L4(23, 3); const v4f l4 = GDN_L4(23, 4); const v4f l5 = GDN_L4(23, 5); __builtin_amdgcn_sched_barrier(0); x23 -= l0.x * x0; x23 -= l0.y * x1; x23 -= l0.z * x2; x23 -= l0.w * x3; x23 -= l1.x * x4; x23 -= l1.y * x5; x23 -= l1.z * x6; x23 -= l1.w * x7; x23 -= l2.x * x8; x23 -= l2.y * x9; x23 -= l2.z * x10; x23 -= l2.w * x11; x23 -= l3.x * x12; x23 -= l3.y * x13; x23 -= l3.z * x14; x23 -= l3.w * x15; x23 -= l4.x * x16; x23 -= l4.y * x17; x23 -= l4.z * x18; x23 -= l4.w * x19; x23 -= l5.x * x20; x23 -= l5.y * x21; x23 -= l5.z * x22; } __builtin_amdgcn_sched_barrier(0);
        float x24 = GDN_RHS(24); { const v4f l0 = GDN_L4(24, 0); const v4f l1 = GDN_L4(24, 1); const v4f l2 = GDN_L4(24, 2); const v4f l3 = GDN_L4(24, 3); const v4f l4 = GDN_L4(24, 4); const v4f l5 = GDN_L4(24, 5); __builtin_amdgcn_sched_barrier(0); x24 -= l0.x * x0; x24 -= l0.y * x1; x24 -= l0.z * x2; x24 -= l0.w * x3; x24 -= l1.x * x4; x24 -= l1.y * x5; x24 -= l1.z * x6; x24 -= l1.w * x7; x24 -= l2.x * x8; x24 -= l2.y * x9; x24 -= l2.z * x10; x24 -= l2.w * x11; x24 -= l3.x * x12; x24 -= l3.y * x13; x24 -= l3.z * x14; x24 -= l3.w * x15; x24 -= l4.x * x16; x24 -= l4.y * x17; x24 -= l4.z * x18; x24 -= l4.w * x19; x24 -= l5.x * x20; x24 -= l5.y * x21; x24 -= l5.z * x22; x24 -= l5.w * x23; } __builtin_amdgcn_sched_barrier(0);
        float x25 = GDN_RHS(25); { const v4f l0 = GDN_L4(25, 0); const v4f l1 = GDN_L4(25, 1); const v4f l2 = GDN_L4(25, 2); const v4f l3 = GDN_L4(25, 3); const v4f l4 = GDN_L4(25, 4); const v4f l5 = GDN_L4(25, 5); __builtin_amdgcn_sched_barrier(0); x25 -= l0.x * x0; x25 -= l0.y * x1; x25 -= l0.z * x2; x25 -= l0.w * x3; x25 -= l1.x * x4; x25 -= l1.y * x5; x25 -= l1.z * x6; x25 -= l1.w * x7; x25 -= l2.x * x8; x25 -= l2.y * x9; x25 -= l2.z * x10; x25 -= l2.w * x11; x25 -= l3.x * x12; x25 -= l3.y * x13; x25 -= l3.z * x14; x25 -= l3.w * x15; x25 -= l4.x * x16; x25 -= l4.y * x17; x25 -= l4.z * x18; x25 -= l4.w * x19; x25 -= l5.x * x20; x25 -= l5.y * x21; x25 -= l5.z * x22; x25 -= l5.w * x23; } __builtin_amdgcn_sched_barrier(0); { const v4f l6 = GDN_L4(25, 6); __builtin_amdgcn_sched_barrier(0); x25 -= l6.x * x24; } __builtin_amdgcn_sched_barrier(0);
        float x26 = GDN_RHS(26); { const v4f l0 = GDN_L4(26, 0); const v4f l1 = GDN_L4(26, 1); const v4f l2 = GDN_L4(26, 2); const v4f l3 = GDN_L4(26, 3); const v4f l4 = GDN_L4(26, 4); const v4f l5 = GDN_L4(26, 5); __builtin_amdgcn_sched_barrier(0); x26 -= l0.x * x0; x26 -= l0.y * x1; x26 -= l0.z * x2; x26 -= l0.w * x3; x26 -= l1.x * x4; x26 -= l1.y * x5; x26 -= l1.z * x6; x26 -= l1.w * x7; x26 -= l2.x * x8; x26 -= l2.y * x9; x26 -= l2.z * x10; x26 -= l2.w * x11; x26 -= l3.x * x12; x26 -= l3.y * x13; x26 -= l3.z * x14; x26 -= l3.w * x15; x26 -= l4.x * x16; x26 -= l4.y * x17; x26 -= l4.z * x18; x26 -= l4.w * x19; x26 -= l5.x * x20; x26 -= l5.y * x21; x26 -= l5.z * x22; x26 -= l5.w * x23; } __builtin_amdgcn_sched_barrier(0); { const v4f l6 = GDN_L4(26, 6); __builtin_amdgcn_sched_barrier(0); x26 -= l6.x * x24; x26 -= l6.y * x25; } __builtin_amdgcn_sched_barrier(0);
        float x27 = GDN_RHS(27); { const v4f l0 = GDN_L4(27, 0); const v4f l1 = GDN_L4(27, 1); const v4f l2 = GDN_L4(27, 2); const v4f l3 = GDN_L4(27, 3); const v4f l4 = GDN_L4(27, 4); const v4f l5 = GDN_L4(27, 5); __builtin_amdgcn_sched_barrier(0); x27 -= l0.x * x0; x27 -= l0.y * x1; x27 -= l0.z * x2; x27 -= l0.w * x3; x27 -= l1.x * x4; x27 -= l1.y * x5; x27 -= l1.z * x6; x27 -= l1.w * x7; x27 -= l2.x * x8; x27 -= l2.y * x9; x27 -= l2.z * x10; x27 -= l2.w * x11; x27 -= l3.x * x12; x27 -= l3.y * x13; x27 -= l3.z * x14; x27 -= l3.w * x15; x27 -= l4.x * x16; x27 -= l4.y * x17; x27 -= l4.z * x18; x27 -= l4.w * x19; x27 -= l5.x * x20; x27 -= l5.y * x21; x27 -= l5.z * x22; x27 -= l5.w * x23; } __builtin_amdgcn_sched_barrier(0); { const v4f l6 = GDN_L4(27, 6); __builtin_amdgcn_sched_barrier(0); x27 -= l6.x * x24; x27 -= l6.y * x25; x27 -= l6.z * x26; } __builtin_amdgcn_sched_barrier(0);
        float x28 = GDN_RHS(28); { const v4f l0 = GDN_L4(28, 0); const v4f l1 = GDN_L4(28, 1); const v4f l2 = GDN_L4(28, 2); const v4f l3 = GDN_L4(28, 3); const v4f l4 = GDN_L4(28, 4); const v4f l5 = GDN_L4(28, 5); __builtin_amdgcn_sched_barrier(0); x28 -= l0.x * x0; x28 -= l0.y * x1; x28 -= l0.z * x2; x28 -= l0.w * x3; x28 -= l1.x * x4; x28 -= l1.y * x5; x28 -= l1.z * x6; x28 -= l1.w * x7; x28 -= l2.x * x8; x28 -= l2.y * x9; x28 -= l2.z * x10; x28 -= l2.w * x11; x28 -= l3.x * x12; x28 -= l3.y * x13; x28 -= l3.z * x14; x28 -= l3.w * x15; x28 -= l4.x * x16; x28 -= l4.y * x17; x28 -= l4.z * x18; x28 -= l4.w * x19; x28 -= l5.x * x20; x28 -= l5.y * x21; x28 -= l5.z * x22; x28 -= l5.w * x23; } __builtin_amdgcn_sched_barrier(0); { const v4f l6 = GDN_L4(28, 6); __builtin_amdgcn_sched_barrier(0); x28 -= l6.x * x24; x28 -= l6.y * x25; x28 -= l6.z * x26; x28 -= l6.w * x27; } __builtin_amdgcn_sched_barrier(0);
        float x29 = GDN_RHS(29); { const v4f l0 = GDN_L4(29, 0); const v4f l1 = GDN_L4(29, 1); const v4f l2 = GDN_L4(29, 2); const v4f l3 = GDN_L4(29, 3); const v4f l4 = GDN_L4(29, 4); const v4f l5 = GDN_L4(29, 5); __builtin_amdgcn_sched_barrier(0); x29 -= l0.x * x0; x29 -= l0.y * x1; x29 -= l0.z * x2; x29 -= l0.w * x3; x29 -= l1.x * x4; x29 -= l1.y * x5; x29 -= l1.z * x6; x29 -= l1.w * x7; x29 -= l2.x * x8; x29 -= l2.y * x9; x29 -= l2.z * x10; x29 -= l2.w * x11; x29 -= l3.x * x12; x29 -= l3.y * x13; x29 -= l3.z * x14; x29 -= l3.w * x15; x29 -= l4.x * x16; x29 -= l4.y * x17; x29 -= l4.z * x18; x29 -= l4.w * x19; x29 -= l5.x * x20; x29 -= l5.y * x21; x29 -= l5.z * x22; x29 -= l5.w * x23; } __builtin_amdgcn_sched_barrier(0); { const v4f l6 = GDN_L4(29, 6); const v4f l7 = GDN_L4(29, 7); __builtin_amdgcn_sched_barrier(0); x29 -= l6.x * x24; x29 -= l6.y * x25; x29 -= l6.z * x26; x29 -= l6.w * x27; x29 -= l7.x * x28; } __builtin_amdgcn_sched_barrier(0);
        float x30 = GDN_RHS(30); { const v4f l0 = GDN_L4(30, 0); const v4f l1 = GDN_L4(30, 1); const v4f l2 = GDN_L4(30, 2); const v4f l3 = GDN_L4(30, 3); const v4f l4 = GDN_L4(30, 4); const v4f l5 = GDN_L4(30, 5); __builtin_amdgcn_sched_barrier(0); x30 -= l0.x * x0; x30 -= l0.y * x1; x30 -= l0.z * x2; x30 -= l0.w * x3; x30 -= l1.x * x4; x30 -= l1.y * x5; x30 -= l1.z * x6; x30 -= l1.w * x7; x30 -= l2.x * x8; x30 -= l2.y * x9; x30 -= l2.z * x10; x30 -= l2.w * x11; x30 -= l3.x * x12; x30 -= l3.y * x13; x30 -= l3.z * x14; x30 -= l3.w * x15; x30 -= l4.x * x16; x30 -= l4.y * x17; x30 -= l4.z * x18; x30 -= l4.w * x19; x30 -= l5.x * x20; x30 -= l5.y * x21; x30 -= l5.z * x22; x30 -= l5.w * x23; } __builtin_amdgcn_sched_barrier(0); { const v4f l6 = GDN_L4(30, 6); const v4f l7 = GDN_L4(30, 7); __builtin_amdgcn_sched_barrier(0); x30 -= l6.x * x24; x30 -= l6.y * x25; x30 -= l6.z * x26; x30 -= l6.w * x27; x30 -= l7.x * x28; x30 -= l7.y * x29; } __builtin_amdgcn_sched_barrier(0);
        float x31 = GDN_RHS(31); { const v4f l0 = GDN_L4(31, 0); const v4f l1 = GDN_L4(31, 1); const v4f l2 = GDN_L4(31, 2); const v4f l3 = GDN_L4(31, 3); const v4f l4 = GDN_L4(31, 4); const v4f l5 = GDN_L4(31, 5); __builtin_amdgcn_sched_barrier(0); x31 -= l0.x * x0; x31 -= l0.y * x1; x31 -= l0.z * x2; x31 -= l0.w * x3; x31 -= l1.x * x4; x31 -= l1.y * x5; x31 -= l1.z * x6; x31 -= l1.w * x7; x31 -= l2.x * x8; x31 -= l2.y * x9; x31 -= l2.z * x10; x31 -= l2.w * x11; x31 -= l3.x * x12; x31 -= l3.y * x13; x31 -= l3.z * x14; x31 -= l3.w * x15; x31 -= l4.x * x16; x31 -= l4.y * x17; x31 -= l4.z * x18; x31 -= l4.w * x19; x31 -= l5.x * x20; x31 -= l5.y * x21; x31 -= l5.z * x22; x31 -= l5.w * x23; } __builtin_amdgcn_sched_barrier(0); { const v4f l6 = GDN_L4(31, 6); const v4f l7 = GDN_L4(31, 7); __builtin_amdgcn_sched_barrier(0); x31 -= l6.x * x24; x31 -= l6.y * x25; x31 -= l6.z * x26; x31 -= l6.w * x27; x31 -= l7.x * x28; x31 -= l7.y * x29; x31 -= l7.z * x30; } __builtin_amdgcn_sched_barrier(0);
        float x32 = GDN_RHS(32); { const v4f l0 = GDN_L4(32, 0); const v4f l1 = GDN_L4(32, 1); const v4f l2 = GDN_L4(32, 2); const v4f l3 = GDN_L4(32, 3); const v4f l4 = GDN_L4(32, 4); const v4f l5 = GDN_L4(32, 5); __builtin_amdgcn_sched_barrier(0); x32 -= l0.x * x0; x32 -= l0.y * x1; x32 -= l0.z * x2; x32 -= l0.w * x3; x32 -= l1.x * x4; x32 -= l1.y * x5; x32 -= l1.z * x6; x32 -= l1.w * x7; x32 -= l2.x * x8; x32 -= l2.y * x9; x32 -= l2.z * x10; x32 -= l2.w * x11; x32 -= l3.x * x12; x32 -= l3.y * x13; x32 -= l3.z * x14; x32 -= l3.w * x15; x32 -= l4.x * x16; x32 -= l4.y * x17; x32 -= l4.z * x18; x32 -= l4.w * x19; x32 -= l5.x * x20; x32 -= l5.y * x21; x32 -= l5.z * x22; x32 -= l5.w * x23; } __builtin_amdgcn_sched_barrier(0); { const v4f l6 = GDN_L4(32, 6); const v4f l7 = GDN_L4(32, 7); __builtin_amdgcn_sched_barrier(0); x32 -= l6.x * x24; x32 -= l6.y * x25; x32 -= l6.z * x26; x32 -= l6.w * x27; x32 -= l7.x * x28; x32 -= l7.y * x29; x32 -= l7.z * x30; x32 -= l7.w * x31; } __builtin_amdgcn_sched_barrier(0);
        float x33 = GDN_RHS(33); { const v4f l0 = GDN_L4(33, 0); const v4f l1 = GDN_L4(33, 1); const v4f l2 = GDN_L4(33, 2); const v4f l3 = GDN_L4(33, 3); const v4f l4 = GDN_L4(33, 4); const v4f l5 = GDN_L4(33, 5); __builtin_amdgcn_sched_barrier(0); x33 -= l0.x * x0; x33 -= l0.y * x1; x33 -= l0.z * x2; x33 -= l0.w * x3; x33 -= l1.x * x4; x33 -= l1.y * x5; x33 -= l1.z * x6; x33 -= l1.w * x7; x33 -= l2.x * x8; x33 -= l2.y * x9; x33 -= l2.z * x10; x33 -= l2.w * x11; x33 -= l3.x * x12; x33 -= l3.y * x13; x33 -= l3.z * x14; x33 -= l3.w * x15; x33 -= l4.x * x16; x33 -= l4.y * x17; x33 -= l4.z * x18; x33 -= l4.w * x19; x33 -= l5.x * x20; x33 -= l5.y * x21; x33 -= l5.z * x22; x33 -= l5.w * x23; } __builtin_amdgcn_sched_barrier(0); { const v4f l6 = GDN_L4(33, 6); const v4f l7 = GDN_L4(33, 7); const v4f l8 = GDN_L4(33, 8); __builtin_amdgcn_sched_barrier(0); x33 -= l6.x * x24; x33 -= l6.y * x25; x33 -= l6.z * x26; x33 -= l6.w * x27; x33 -= l7.x * x28; x33 -= l7.y * x29; x33 -= l7.z * x30; x33 -= l7.w * x31; x33 -= l8.x * x32; } __builtin_amdgcn_sched_barrier(0);
        float x34 = GDN_RHS(34); { const v4f l0 = GDN_L4(34, 0); const v4f l1 = GDN_L4(34, 1); const v4f l2 = GDN_L4(34, 2); const v4f l3 = GDN_L4(34, 3); const v4f l4 = GDN_L4(34, 4); const v4f l5 = GDN_L4(34, 5); __builtin_amdgcn_sched_barrier(0); x34 -= l0.x * x0; x34 -= l0.y * x1; x34 -= l0.z * x2; x34 -= l0.w * x3; x34 -= l1.x * x4; x34 -= l1.y * x5; x34 -= l1.z * x6; x34 -= l1.w * x7; x34 -= l2.x * x8; x34 -= l2.y * x9; x34 -= l2.z * x10; x34 -= l2.w * x11; x34 -= l3.x * x12; x34 -= l3.y * x13; x34 -= l3.z * x14; x34 -= l3.w * x15; x34 -= l4.x * x16; x34 -= l4.y * x17; x34 -= l4.z * x18; x34 -= l4.w * x19; x34 -= l5.x * x20; x34 -= l5.y * x21; x34 -= l5.z * x22; x34 -= l5.w * x23; } __builtin_amdgcn_sched_barrier(0); { const v4f l6 = GDN_L4(34, 6); const v4f l7 = GDN_L4(34, 7); const v4f l8 = GDN_L4(34, 8); __builtin_amdgcn_sched_barrier(0); x34 -= l6.x * x24; x34 -= l6.y * x25; x34 -= l6.z * x26; x34 -= l6.w * x27; x34 -= l7.x * x28; x34 -= l7.y * x29; x34 -= l7.z * x30; x34 -= l7.w * x31; x34 -= l8.x * x32; x34 -= l8.y * x33; } __builtin_amdgcn_sched_barrier(0);
        float x35 = GDN_RHS(35); { const v4f l0 = GDN_L4(35, 0); const v4f l1 = GDN_L4(35, 1); const v4f l2 = GDN_L4(35, 2); const v4f l3 = GDN_L4(35, 3); const v4f l4 = GDN_L4(35, 4); const v4f l5 = GDN_L4(35, 5); __builtin_amdgcn_sched_barrier(0); x35 -= l0.x * x0; x35 -= l0.y * x1; x35 -= l0.z * x2; x35 -= l0.w * x3; x35 -= l1.x * x4; x35 -= l1.y * x5; x35 -= l1.z * x6; x35 -= l1.w * x7; x35 -= l2.x * x8; x35 -= l2.y * x9; x35 -= l2.z * x10; x35 -= l2.w * x11; x35 -= l3.x * x12; x35 -= l3.y * x13; x35 -= l3.z * x14; x35 -= l3.w * x15; x35 -= l4.x * x16; x35 -= l4.y * x17; x35 -= l4.z * x18; x35 -= l4.w * x19; x35 -= l5.x * x20; x35 -= l5.y * x21; x35 -= l5.z * x22; x35 -= l5.w * x23; } __builtin_amdgcn_sched_barrier(0); { const v4f l6 = GDN_L4(35, 6); const v4f l7 = GDN_L4(35, 7); const v4f l8 = GDN_L4(35, 8); __builtin_amdgcn_sched_barrier(0); x35 -= l6.x * x24; x35 -= l6.y * x25; x35 -= l6.z * x26; x35 -= l6.w * x27; x35 -= l7.x * x28; x35 -= l7.y * x29; x35 -= l7.z * x30; x35 -= l7.w * x31; x35 -= l8.x * x32; x35 -= l8.y * x33; x35 -= l8.z * x34; } __builtin_amdgcn_sched_barrier(0);
        float x36 = GDN_RHS(36); { const v4f l0 = GDN_L4(36, 0); const v4f l1 = GDN_L4(36, 1); const v4f l2 = GDN_L4(36, 2); const v4f l3 = GDN_L4(36, 3); const v4f l4 = GDN_L4(36, 4); const v4f l5 = GDN_L4(36, 5); __builtin_amdgcn_sched_barrier(0); x36 -= l0.x * x0; x36 -= l0.y * x1; x36 -= l0.z * x2; x36 -= l0.w * x3; x36 -= l1.x * x4; x36 -= l1.y * x5; x36 -= l1.z * x6; x36 -= l1.w * x7; x36 -= l2.x * x8; x36 -= l2.y * x9; x36 -= l2.z * x10; x36 -= l2.w * x11; x36 -= l3.x * x12; x36 -= l3.y * x13; x36 -= l3.z * x14; x36 -= l3.w * x15; x36 -= l4.x * x16; x36 -= l4.y * x17; x36 -= l4.z * x18; x36 -= l4.w * x19; x36 -= l5.x * x20; x36 -= l5.y * x21; x36 -= l5.z * x22; x36 -= l5.w * x23; } __builtin_amdgcn_sched_barrier(0); { const v4f l6 = GDN_L4(36, 6); const v4f l7 = GDN_L4(36, 7); const v4f l8 = GDN_L4(36, 8); __builtin_amdgcn_sched_barrier(0); x36 -= l6.x * x24; x36 -= l6.y * x25; x36 -= l6.z * x26; x36 -= l6.w * x27; x36 -= l7.x * x28; x36 -= l7.y * x29; x36 -= l7.z * x30; x36 -= l7.w * x31; x36 -= l8.x * x32; x36 -= l8.y * x33; x36 -= l8.z * x34; x36 -= l8.w * x35; } __builtin_amdgcn_sched_barrier(0);
        float x37 = GDN_RHS(37); { const v4f l0 = GDN_L4(37, 0); const v4f l1 = GDN_L4(37, 1); const v4f l2 = GDN_L4(37, 2); const v4f l3 = GDN_L4(37, 3); const v4f l4 = GDN_L4(37, 4); const v4f l5 = GDN_L4(37, 5); __builtin_amdgcn_sched_barrier(0); x37 -= l0.x * x0; x37 -= l0.y * x1; x37 -= l0.z * x2; x37 -= l0.w * x3; x37 -= l1.x * x4; x37 -= l1.y * x5; x37 -= l1.z * x6; x37 -= l1.w * x7; x37 -= l2.x * x8; x37 -= l2.y * x9; x37 -= l2.z * x10; x37 -= l2.w * x11; x37 -= l3.x * x12; x37 -= l3.y * x13; x37 -= l3.z * x14; x37 -= l3.w * x15; x37 -= l4.x * x16; x37 -= l4.y * x17; x37 -= l4.z * x18; x37 -= l4.w * x19; x37 -= l5.x * x20; x37 -= l5.y * x21; x37 -= l5.z * x22; x37 -= l5.w * x23; } __builtin_amdgcn_sched_barrier(0); { const v4f l6 = GDN_L4(37, 6); const v4f l7 = GDN_L4(37, 7); const v4f l8 = GDN_L4(37, 8); const v4f l9 = GDN_L4(37, 9); __builtin_amdgcn_sched_barrier(0); x37 -= l6.x * x24; x37 -= l6.y * x25; x37 -= l6.z * x26; x37 -= l6.w * x27; x37 -= l7.x * x28; x37 -= l7.y * x29; x37 -= l7.z * x30; x37 -= l7.w * x31; x37 -= l8.x * x32; x37 -= l8.y * x33; x37 -= l8.z * x34; x37 -= l8.w * x35; x37 -= l9.x * x36; } __builtin_amdgcn_sched_barrier(0);
        float x38 = GDN_RHS(38); { const v4f l0 = GDN_L4(38, 0); const v4f l1 = GDN_L4(38, 1); const v4f l2 = GDN_L4(38, 2); const v4f l3 = GDN_L4(38, 3); const v4f l4 = GDN_L4(38, 4); const v4f l5 = GDN_L4(38, 5); __builtin_amdgcn_sched_barrier(0); x38 -= l0.x * x0; x38 -= l0.y * x1; x38 -= l0.z * x2; x38 -= l0.w * x3; x38 -= l1.x * x4; x38 -= l1.y * x5; x38 -= l1.z * x6; x38 -= l1.w * x7; x38 -= l2.x * x8; x38 -= l2.y * x9; x38 -= l2.z * x10; x38 -= l2.w * x11; x38 -= l3.x * x12; x38 -= l3.y * x13; x38 -= l3.z * x14; x38 -= l3.w * x15; x38 -= l4.x * x16; x38 -= l4.y * x17; x38 -= l4.z * x18; x38 -= l4.w * x19; x38 -= l5.x * x20; x38 -= l5.y * x21; x38 -= l5.z * x22; x38 -= l5.w * x23; } __builtin_amdgcn_sched_barrier(0); { const v4f l6 = GDN_L4(38, 6); const v4f l7 = GDN_L4(38, 7); const v4f l8 = GDN_L4(38, 8); const v4f l9 = GDN_L4(38, 9); __builtin_amdgcn_sched_barrier(0); x38 -= l6.x * x24; x38 -= l6.y * x25; x38 -= l6.z * x26; x38 -= l6.w * x27; x38 -= l7.x * x28; x38 -= l7.y * x29; x38 -= l7.z * x30; x38 -= l7.w * x31; x38 -= l8.x * x32; x38 -= l8.y * x33; x38 -= l8.z * x34; x38 -= l8.w * x35; x38 -= l9.x * x36; x38 -= l9.y * x37; } __builtin_amdgcn_sched_barrier(0);
        float x39 = GDN_RHS(39); { const v4f l0 = GDN_L4(39, 0); const v4f l1 = GDN_L4(39, 1); const v4f l2 = GDN_L4(39, 2); const v4f l3 = GDN_L4(39, 3); const v4f l4 = GDN_L4(39, 4); const v4f l5 = GDN_L4(39, 5); __builtin_amdgcn_sched_barrier(0); x39 -= l0.x * x0; x39 -= l0.y * x1; x39 -= l0.z * x2; x39 -= l0.w * x3; x39 -= l1.x * x4; x39 -= l1.y * x5; x39 -= l1.z * x6; x39 -= l1.w * x7; x39 -= l2.x * x8; x39 -= l2.y * x9; x39 -= l2.z * x10; x39 -= l2.w * x11; x39 -= l3.x * x12; x39 -= l3.y * x13; x39 -= l3.z * x14; x39 -= l3.w * x15; x39 -= l4.x * x16; x39 -= l4.y * x17; x39 -= l4.z * x18; x39 -= l4.w * x19; x39 -= l5.x * x20; x39 -= l5.y * x21; x39 -= l5.z * x22; x39 -= l5.w * x23; } __builtin_amdgcn_sched_barrier(0); { const v4f l6 = GDN_L4(39, 6); const v4f l7 = GDN_L4(39, 7); const v4f l8 = GDN_L4(39, 8); const v4f l9 = GDN_L4(39, 9); __builtin_amdgcn_sched_barrier(0); x39 -= l6.x * x24; x39 -= l6.y * x25; x39 -= l6.z * x26; x39 -= l6.w * x27; x39 -= l7.x * x28; x39 -= l7.y * x29; x39 -= l7.z * x30; x39 -= l7.w * x31; x39 -= l8.x * x32; x39 -= l8.y * x33; x39 -= l8.z * x34; x39 -= l8.w * x35; x39 -= l9.x * x36; x39 -= l9.y * x37; x39 -= l9.z * x38; } __builtin_amdgcn_sched_barrier(0);
        float x40 = GDN_RHS(40); { const v4f l0 = GDN_L4(40, 0); const v4f l1 = GDN_L4(40, 1); const v4f l2 = GDN_L4(40, 2); const v4f l3 = GDN_L4(40, 3); const v4f l4 = GDN_L4(40, 4); const v4f l5 = GDN_L4(40, 5); __builtin_amdgcn_sched_barrier(0); x40 -= l0.x * x0; x40 -= l0.y * x1; x40 -= l0.z * x2; x40 -= l0.w * x3; x40 -= l1.x * x4; x40 -= l1.y * x5; x40 -= l1.z * x6; x40 -= l1.w * x7; x40 -= l2.x * x8; x40 -= l2.y * x9; x40 -= l2.z * x10; x40 -= l2.w * x11; x40 -= l3.x * x12; x40 -= l3.y * x13; x40 -= l3.z * x14; x40 -= l3.w * x15; x40 -= l4.x * x16; x40 -= l4.y * x17; x40 -= l4.z * x18; x40 -= l4.w * x19; x40 -= l5.x * x20; x40 -= l5.y * x21; x40 -= l5.z * x22; x40 -= l5.w * x23; } __builtin_amdgcn_sched_barrier(0); { const v4f l6 = GDN_L4(40, 6); const v4f l7 = GDN_L4(40, 7); const v4f l8 = GDN_L4(40, 8); const v4f l9 = GDN_L4(40, 9); __builtin_amdgcn_sched_barrier(0); x40 -= l6.x * x24; x40 -= l6.y * x25; x40 -= l6.z * x26; x40 -= l6.w * x27; x40 -= l7.x * x28; x40 -= l7.y * x29; x40 -= l7.z * x30; x40 -= l7.w * x31; x40 -= l8.x * x32; x40 -= l8.y * x33; x40 -= l8.z * x34; x40 -= l8.w * x35; x40 -= l9.x * x36; x40 -= l9.y * x37; x40 -= l9.z * x38; x40 -= l9.w * x39; } __builtin_amdgcn_sched_barrier(0);
        float x41 = GDN_RHS(41); { const v4f l0 = GDN_L4(41, 0); const v4f l1 = GDN_L4(41, 1); const v4f l2 = GDN_L4(41, 2); const v4f l3 = GDN_L4(41, 3); const v4f l4 = GDN_L4(41, 4); const v4f l5 = GDN_L4(41, 5); __builtin_amdgcn_sched_barrier(0); x41 -= l0.x * x0; x41 -= l0.y * x1; x41 -= l0.z * x2; x41 -= l0.w * x3; x41 -= l1.x * x4; x41 -= l1.y * x5; x41 -= l1.z * x6; x41 -= l1.w * x7; x41 -= l2.x * x8; x41 -= l2.y * x9; x41 -= l2.z * x10; x41 -= l2.w * x11; x41 -= l3.x * x12; x41 -= l3.y * x13; x41 -= l3.z * x14; x41 -= l3.w * x15; x41 -= l4.x * x16; x41 -= l4.y * x17; x41 -= l4.z * x18; x41 -= l4.w * x19; x41 -= l5.x * x20; x41 -= l5.y * x21; x41 -= l5.z * x22; x41 -= l5.w * x23; } __builtin_amdgcn_sched_barrier(0); { const v4f l6 = GDN_L4(41, 6); const v4f l7 = GDN_L4(41, 7); const v4f l8 = GDN_L4(41, 8); const v4f l9 = GDN_L4(41, 9); const v4f l10 = GDN_L4(41, 10); __builtin_amdgcn_sched_barrier(0); x41 -= l6.x * x24; x41 -= l6.y * x25; x41 -= l6.z * x26; x41 -= l6.w * x27; x41 -= l7.x * x28; x41 -= l7.y * x29; x41 -= l7.z * x30; x41 -= l7.w * x31; x41 -= l8.x * x32; x41 -= l8.y * x33; x41 -= l8.z * x34; x41 -= l8.w * x35; x41 -= l9.x * x36; x41 -= l9.y * x37; x41 -= l9.z * x38; x41 -= l9.w * x39; x41 -= l10.x * x40; } __builtin_amdgcn_sched_barrier(0);
        float x42 = GDN_RHS(42); { const v4f l0 = GDN_L4(42, 0); const v4f l1 = GDN_L4(42, 1); const v4f l2 = GDN_L4(42, 2); const v4f l3 = GDN_L4(42, 3); const v4f l4 = GDN_L4(42, 4); const v4f l5 = GDN_L4(42, 5); __builtin_amdgcn_sched_barrier(0); x42 -= l0.x * x0; x42 -= l0.y * x1; x42 -= l0.z * x2; x42 -= l0.w * x3; x42 -= l1.x * x4; x42 -= l1.y * x5; x42 -= l1.z * x6; x42 -= l1.w * x7; x42 -= l2.x * x8; x42 -= l2.y * x9; x42 -= l2.z * x10; x42 -= l2.w * x11; x42 -= l3.x * x12; x42 -= l3.y * x13; x42 -= l3.z * x14; x42 -= l3.w * x15; x42 -= l4.x * x16; x42 -= l4.y * x17; x42 -= l4.z * x18; x42 -= l4.w * x19; x42 -= l5.x * x20; x42 -= l5.y * x21; x42 -= l5.z * x22; x42 -= l5.w * x23; } __builtin_amdgcn_sched_barrier(0); { const v4f l6 = GDN_L4(42, 6); const v4f l7 = GDN_L4(42, 7); const v4f l8 = GDN_L4(42, 8); const v4f l9 = GDN_L4(42, 9); const v4f l10 = GDN_L4(42, 10); __builtin_amdgcn_sched_barrier(0); x42 -= l6.x * x24; x42 -= l6.y * x25; x42 -= l6.z * x26; x42 -= l6.w * x27; x42 -= l7.x * x28; x42 -= l7.y * x29; x42 -= l7.z * x30; x42 -= l7.w * x31; x42 -= l8.x * x32; x42 -= l8.y * x33; x42 -= l8.z * x34; x42 -= l8.w * x35; x42 -= l9.x * x36; x42 -= l9.y * x37; x42 -= l9.z * x38; x42 -= l9.w * x39; x42 -= l10.x * x40; x42 -= l10.y * x41; } __builtin_amdgcn_sched_barrier(0);
        float x43 = GDN_RHS(43); { const v4f l0 = GDN_L4(43, 0); const v4f l1 = GDN_L4(43, 1); const v4f l2 = GDN_L4(43, 2); const v4f l3 = GDN_L4(43, 3); const v4f l4 = GDN_L4(43, 4); const v4f l5 = GDN_L4(43, 5); __builtin_amdgcn_sched_barrier(0); x43 -= l0.x * x0; x43 -= l0.y * x1; x43 -= l0.z * x2; x43 -= l0.w * x3; x43 -= l1.x * x4; x43 -= l1.y * x5; x43 -= l1.z * x6; x43 -= l1.w * x7; x43 -= l2.x * x8; x43 -= l2.y * x9; x43 -= l2.z * x10; x43 -= l2.w * x11; x43 -= l3.x * x12; x43 -= l3.y * x13; x43 -= l3.z * x14; x43 -= l3.w * x15; x43 -= l4.x * x16; x43 -= l4.y * x17; x43 -= l4.z * x18; x43 -= l4.w * x19; x43 -= l5.x * x20; x43 -= l5.y * x21; x43 -= l5.z * x22; x43 -= l5.w * x23; } __builtin_amdgcn_sched_barrier(0); { const v4f l6 = GDN_L4(43, 6); const v4f l7 = GDN_L4(43, 7); const v4f l8 = GDN_L4(43, 8); const v4f l9 = GDN_L4(43, 9); const v4f l10 = GDN_L4(43, 10); __builtin_amdgcn_sched_barrier(0); x43 -= l6.x * x24; x43 -= l6.y * x25; x43 -= l6.z * x26; x43 -= l6.w * x27; x43 -= l7.x * x28; x43 -= l7.y * x29; x43 -= l7.z * x30; x43 -= l7.w * x31; x43 -= l8.x * x32; x43 -= l8.y * x33; x43 -= l8.z * x34; x43 -= l8.w * x35; x43 -= l9.x * x36; x43 -= l9.y * x37; x43 -= l9.z * x38; x43 -= l9.w * x39; x43 -= l10.x * x40; x43 -= l10.y * x41; x43 -= l10.z * x42; } __builtin_amdgcn_sched_barrier(0);
        float x44 = GDN_RHS(44); { const v4f l0 = GDN_L4(44, 0); const v4f l1 = GDN_L4(44, 1); const v4f l2 = GDN_L4(44, 2); const v4f l3 = GDN_L4(44, 3); const v4f l4 = GDN_L4(44, 4); const v4f l5 = GDN_L4(44, 5); __builtin_amdgcn_sched_barrier(0); x44 -= l0.x * x0; x44 -= l0.y * x1; x44 -= l0.z * x2; x44 -= l0.w * x3; x44 -= l1.x * x4; x44 -= l1.y * x5; x44 -= l1.z * x6; x44 -= l1.w * x7; x44 -= l2.x * x8; x44 -= l2.y * x9; x44 -= l2.z * x10; x44 -= l2.w * x11; x44 -= l3.x * x12; x44 -= l3.y * x13; x44 -= l3.z * x14; x44 -= l3.w * x15; x44 -= l4.x * x16; x44 -= l4.y * x17; x44 -= l4.z * x18; x44 -= l4.w * x19; x44 -= l5.x * x20; x44 -= l5.y * x21; x44 -= l5.z * x22; x44 -= l5.w * x23; } __builtin_amdgcn_sched_barrier(0); { const v4f l6 = GDN_L4(44, 6); const v4f l7 = GDN_L4(44, 7); const v4f l8 = GDN_L4(44, 8); const v4f l9 = GDN_L4(44, 9); const v4f l10 = GDN_L4(44, 10); __builtin_amdgcn_sched_barrier(0); x44 -= l6.x * x24; x44 -= l6.y * x25; x44 -= l6.z * x26; x44 -= l6.w * x27; x44 -= l7.x * x28; x44 -= l7.y * x29; x44 -= l7.z * x30; x44 -= l7.w * x31; x44 -= l8.x * x32; x44 -= l8.y * x33; x44 -= l8.z * x34; x44 -= l8.w * x35; x44 -= l9.x * x36; x44 -= l9.y * x37; x44 -= l9.z * x38; x44 -= l9.w * x39; x44 -= l10.x * x40; x44 -= l10.y * x41; x44 -= l10.z * x42; x44 -= l10.w * x43; } __builtin_amdgcn_sched_barrier(0);
        float x45 = GDN_RHS(45); { const v4f l0 = GDN_L4(45, 0); const v4f l1 = GDN_L4(45, 1); const v4f l2 = GDN_L4(45, 2); const v4f l3 = GDN_L4(45, 3); const v4f l4 = GDN_L4(45, 4); const v4f l5 = GDN_L4(45, 5); __builtin_amdgcn_sched_barrier(0); x45 -= l0.x * x0; x45 -= l0.y * x1; x45 -= l0.z * x2; x45 -= l0.w * x3; x45 -= l1.x * x4; x45 -= l1.y * x5; x45 -= l1.z * x6; x45 -= l1.w * x7; x45 -= l2.x * x8; x45 -= l2.y * x9; x45 -= l2.z * x10; x45 -= l2.w * x11; x45 -= l3.x * x12; x45 -= l3.y * x13; x45 -= l3.z * x14; x45 -= l3.w * x15; x45 -= l4.x * x16; x45 -= l4.y * x17; x45 -= l4.z * x18; x45 -= l4.w * x19; x45 -= l5.x * x20; x45 -= l5.y * x21; x45 -= l5.z * x22; x45 -= l5.w * x23; } __builtin_amdgcn_sched_barrier(0); { const v4f l6 = GDN_L4(45, 6); const v4f l7 = GDN_L4(45, 7); const v4f l8 = GDN_L4(45, 8); const v4f l9 = GDN_L4(45, 9); const v4f l10 = GDN_L4(45, 10); const v4f l11 = GDN_L4(45, 11); __builtin_amdgcn_sched_barrier(0); x45 -= l6.x * x24; x45 -= l6.y * x25; x45 -= l6.z * x26; x45 -= l6.w * x27; x45 -= l7.x * x28; x45 -= l7.y * x29; x45 -= l7.z * x30; x45 -= l7.w * x31; x45 -= l8.x * x32; x45 -= l8.y * x33; x45 -= l8.z * x34; x45 -= l8.w * x35; x45 -= l9.x * x36; x45 -= l9.y * x37; x45 -= l9.z * x38; x45 -= l9.w * x39; x45 -= l10.x * x40; x45 -= l10.y * x41; x45 -= l10.z * x42; x45 -= l10.w * x43; x45 -= l11.x * x44; } __builtin_amdgcn_sched_barrier(0);
        float x46 = GDN_RHS(46); { const v4f l0 = GDN_L4(46, 0); const v4f l1 = GDN_L4(46, 1); const v4f l2 = GDN_L4(46, 2); const v4f l3 = GDN_L4(46, 3); const v4f l4 = GDN_L4(46, 4); const v4f l5 = GDN_L4(46, 5); __builtin_amdgcn_sched_barrier(0); x46 -= l0.x * x0; x46 -= l0.y * x1; x46 -= l0.z * x2; x46 -= l0.w * x3; x46 -= l1.x * x4; x46 -= l1.y * x5; x46 -= l1.z * x6; x46 -= l1.w * x7; x46 -= l2.x * x8; x46 -= l2.y * x9; x46 -= l2.z * x10; x46 -= l2.w * x11; x46 -= l3.x * x12; x46 -= l3.y * x13; x46 -= l3.z * x14; x46 -= l3.w * x15; x46 -= l4.x * x16; x46 -= l4.y * x17; x46 -= l4.z * x18; x46 -= l4.w * x19; x46 -= l5.x * x20; x46 -= l5.y * x21; x46 -= l5.z * x22; x46 -= l5.w * x23; } __builtin_amdgcn_sched_barrier(0); { const v4f l6 = GDN_L4(46, 6); const v4f l7 = GDN_L4(46, 7); const v4f l8 = GDN_L4(46, 8); const v4f l9 = GDN_L4(46, 9); const v4f l10 = GDN_L4(46, 10); const v4f l11 = GDN_L4(46, 11); __builtin_amdgcn_sched_barrier(0); x46 -= l6.x * x24; x46 -= l6.y * x25; x46 -= l6.z * x26; x46 -= l6.w * x27; x46 -= l7.x * x28; x46 -= l7.y * x29; x46 -= l7.z * x30; x46 -= l7.w * x31; x46 -= l8.x * x32; x46 -= l8.y * x33; x46 -= l8.z * x34; x46 -= l8.w * x35; x46 -= l9.x * x36; x46 -= l9.y * x37; x46 -= l9.z * x38; x46 -= l9.w * x39; x46 -= l10.x * x40; x46 -= l10.y * x41; x46 -= l10.z * x42; x46 -= l10.w * x43; x46 -= l11.x * x44; x46 -= l11.y * x45; } __builtin_amdgcn_sched_barrier(0);
        float x47 = GDN_RHS(47); { const v4f l0 = GDN_L4(47, 0); const v4f l1 = GDN_L4(47, 1); const v4f l2 = GDN_L4(47, 2); const v4f l3 = GDN_L4(47, 3); const v4f l4 = GDN_L4(47, 4); const v4f l5 = GDN_L4(47, 5); __builtin_amdgcn_sched_barrier(0); x47 -= l0.x * x0; x47 -= l0.y * x1; x47 -= l0.z * x2; x47 -= l0.w * x3; x47 -= l1.x * x4; x47 -= l1.y * x5; x47 -= l1.z * x6; x47 -= l1.w * x7; x47 -= l2.x * x8; x47 -= l2.y * x9; x47 -= l2.z * x10; x47 -= l2.w * x11; x47 -= l3.x * x12; x47 -= l3.y * x13; x47 -= l3.z * x14; x47 -= l3.w * x15; x47 -= l4.x * x16; x47 -= l4.y * x17; x47 -= l4.z * x18; x47 -= l4.w * x19; x47 -= l5.x * x20; x47 -= l5.y * x21; x47 -= l5.z * x22; x47 -= l5.w * x23; } __builtin_amdgcn_sched_barrier(0); { const v4f l6 = GDN_L4(47, 6); const v4f l7 = GDN_L4(47, 7); const v4f l8 = GDN_L4(47, 8); const v4f l9 = GDN_L4(47, 9); const v4f l10 = GDN_L4(47, 10); const v4f l11 = GDN_L4(47, 11); __builtin_amdgcn_sched_barrier(0); x47 -= l6.x * x24; x47 -= l6.y * x25; x47 -= l6.z * x26; x47 -= l6.w * x27; x47 -= l7.x * x28; x47 -= l7.y * x29; x47 -= l7.z * x30; x47 -= l7.w * x31; x47 -= l8.x * x32; x47 -= l8.y * x33; x47 -= l8.z * x34; x47 -= l8.w * x35; x47 -= l9.x * x36; x47 -= l9.y * x37; x47 -= l9.z * x38; x47 -= l9.w * x39; x47 -= l10.x * x40; x47 -= l10.y * x41; x47 -= l10.z * x42; x47 -= l10.w * x43; x47 -= l11.x * x44; x47 -= l11.y * x45; x47 -= l11.z * x46; } __builtin_amdgcn_sched_barrier(0);
        float x48 = GDN_RHS(48); { const v4f l0 = GDN_L4(48, 0); const v4f l1 = GDN_L4(48, 1); const v4f l2 = GDN_L4(48, 2); const v4f l3 = GDN_L4(48, 3); const v4f l4 = GDN_L4(48, 4); const v4f l5 = GDN_L4(48, 5); __builtin_amdgcn_sched_barrier(0); x48 -= l0.x * x0; x48 -= l0.y * x1; x48 -= l0.z * x2; x48 -= l0.w * x3; x48 -= l1.x * x4; x48 -= l1.y * x5; x48 -= l1.z * x6; x48 -= l1.w * x7; x48 -= l2.x * x8; x48 -= l2.y * x9; x48 -= l2.z * x10; x48 -= l2.w * x11; x48 -= l3.x * x12; x48 -= l3.y * x13; x48 -= l3.z * x14; x48 -= l3.w * x15; x48 -= l4.x * x16; x48 -= l4.y * x17; x48 -= l4.z * x18; x48 -= l4.w * x19; x48 -= l5.x * x20; x48 -= l5.y * x21; x48 -= l5.z * x22; x48 -= l5.w * x23; } __builtin_amdgcn_sched_barrier(0); { const v4f l6 = GDN_L4(48, 6); const v4f l7 = GDN_L4(48, 7); const v4f l8 = GDN_L4(48, 8); const v4f l9 = GDN_L4(48, 9); const v4f l10 = GDN_L4(48, 10); const v4f l11 = GDN_L4(48, 11); __builtin_amdgcn_sched_barrier(0); x48 -= l6.x * x24; x48 -= l6.y * x25; x48 -= l6.z * x26; x48 -= l6.w * x27; x48 -= l7.x * x28; x48 -= l7.y * x29; x48 -= l7.z * x30; x48 -= l7.w * x31; x48 -= l8.x * x32; x48 -= l8.y * x33; x48 -= l8.z * x34; x48 -= l8.w * x35; x48 -= l9.x * x36; x48 -= l9.y * x37; x48 -= l9.z * x38; x48 -= l9.w * x39; x48 -= l10.x * x40; x48 -= l10.y * x41; x48 -= l10.z * x42; x48 -= l10.w * x43; x48 -= l11.x * x44; x48 -= l11.y * x45; x48 -= l11.z * x46; x48 -= l11.w * x47; } __builtin_amdgcn_sched_barrier(0);
        float x49 = GDN_RHS(49); { const v4f l0 = GDN_L4(49, 0); const v4f l1 = GDN_L4(49, 1); const v4f l2 = GDN_L4(49, 2); const v4f l3 = GDN_L4(49, 3); const v4f l4 = GDN_L4(49, 4); const v4f l5 = GDN_L4(49, 5); __builtin_amdgcn_sched_barrier(0); x49 -= l0.x * x0; x49 -= l0.y * x1; x49 -= l0.z * x2; x49 -= l0.w * x3; x49 -= l1.x * x4; x49 -= l1.y * x5; x49 -= l1.z * x6; x49 -= l1.w * x7; x49 -= l2.x * x8; x49 -= l2.y * x9; x49 -= l2.z * x10; x49 -= l2.w * x11; x49 -= l3.x * x12; x49 -= l3.y * x13; x49 -= l3.z * x14; x49 -= l3.w * x15; x49 -= l4.x * x16; x49 -= l4.y * x17; x49 -= l4.z * x18; x49 -= l4.w * x19; x49 -= l5.x * x20; x49 -= l5.y * x21; x49 -= l5.z * x22; x49 -= l5.w * x23; } __builtin_amdgcn_sched_barrier(0); { const v4f l6 = GDN_L4(49, 6); const v4f l7 = GDN_L4(49, 7); const v4f l8 = GDN_L4(49, 8); const v4f l9 = GDN_L4(49, 9); const v4f l10 = GDN_L4(49, 10); const v4f l11 = GDN_L4(49, 11); __builtin_amdgcn_sched_barrier(0); x49 -= l6.x * x24; x49 -= l6.y * x25; x49 -= l6.z * x26; x49 -= l6.w * x27; x49 -= l7.x * x28; x49 -= l7.y * x29; x49 -= l7.z * x30; x49 -= l7.w * x31; x49 -= l8.x * x32; x49 -= l8.y * x33; x49 -= l8.z * x34; x49 -= l8.w * x35; x49 -= l9.x * x36; x49 -= l9.y * x37; x49 -= l9.z * x38; x49 -= l9.w * x39; x49 -= l10.x * x40; x49 -= l10.y * x41; x49 -= l10.z * x42; x49 -= l10.w * x43; x49 -= l11.x * x44; x49 -= l11.y * x45; x49 -= l11.z * x46; x49 -= l11.w * x47; } __builtin_amdgcn_sched_barrier(0); { const v4f l12 = GDN_L4(49, 12); __builtin_amdgcn_sched_barrier(0); x49 -= l12.x * x48; } __builtin_amdgcn_sched_barrier(0);
        float x50 = GDN_RHS(50); { const v4f l0 = GDN_L4(50, 0); const v4f l1 = GDN_L4(50, 1); const v4f l2 = GDN_L4(50, 2); const v4f l3 = GDN_L4(50, 3); const v4f l4 = GDN_L4(50, 4); const v4f l5 = GDN_L4(50, 5); __builtin_amdgcn_sched_barrier(0); x50 -= l0.x * x0; x50 -= l0.y * x1; x50 -= l0.z * x2; x50 -= l0.w * x3; x50 -= l1.x * x4; x50 -= l1.y * x5; x50 -= l1.z * x6; x50 -= l1.w * x7; x50 -= l2.x * x8; x50 -= l2.y * x9; x50 -= l2.z * x10; x50 -= l2.w * x11; x50 -= l3.x * x12; x50 -= l3.y * x13; x50 -= l3.z * x14; x50 -= l3.w * x15; x50 -= l4.x * x16; x50 -= l4.y * x17; x50 -= l4.z * x18; x50 -= l4.w * x19; x50 -= l5.x * x20; x50 -= l5.y * x21; x50 -= l5.z * x22; x50 -= l5.w * x23; } __builtin_amdgcn_sched_barrier(0); { const v4f l6 = GDN_L4(50, 6); const v4f l7 = GDN_L4(50, 7); const v4f l8 = GDN_L4(50, 8); const v4f l9 = GDN_L4(50, 9); const v4f l10 = GDN_L4(50, 10); const v4f l11 = GDN_L4(50, 11); __builtin_amdgcn_sched_barrier(0); x50 -= l6.x * x24; x50 -= l6.y * x25; x50 -= l6.z * x26; x50 -= l6.w * x27; x50 -= l7.x * x28; x50 -= l7.y * x29; x50 -= l7.z * x30; x50 -= l7.w * x31; x50 -= l8.x * x32; x50 -= l8.y * x33; x50 -= l8.z * x34; x50 -= l8.w * x35; x50 -= l9.x * x36; x50 -= l9.y * x37; x50 -= l9.z * x38; x50 -= l9.w * x39; x50 -= l10.x * x40; x50 -= l10.y * x41; x50 -= l10.z * x42; x50 -= l10.w * x43; x50 -= l11.x * x44; x50 -= l11.y * x45; x50 -= l11.z * x46; x50 -= l11.w * x47; } __builtin_amdgcn_sched_barrier(0); { const v4f l12 = GDN_L4(50, 12); __builtin_amdgcn_sched_barrier(0); x50 -= l12.x * x48; x50 -= l12.y * x49; } __builtin_amdgcn_sched_barrier(0);
        float x51 = GDN_RHS(51); { const v4f l0 = GDN_L4(51, 0); const v4f l1 = GDN_L4(51, 1); const v4f l2 = GDN_L4(51, 2); const v4f l3 = GDN_L4(51, 3); const v4f l4 = GDN_L4(51, 4); const v4f l5 = GDN_L4(51, 5); __builtin_amdgcn_sched_barrier(0); x51 -= l0.x * x0; x51 -= l0.y * x1; x51 -= l0.z * x2; x51 -= l0.w * x3; x51 -= l1.x * x4; x51 -= l1.y * x5; x51 -= l1.z * x6; x51 -= l1.w * x7; x51 -= l2.x * x8; x51 -= l2.y * x9; x51 -= l2.z * x10; x51 -= l2.w * x11; x51 -= l3.x * x12; x51 -= l3.y * x13; x51 -= l3.z * x14; x51 -= l3.w * x15; x51 -= l4.x * x16; x51 -= l4.y * x17; x51 -= l4.z * x18; x51 -= l4.w * x19; x51 -= l5.x * x20; x51 -= l5.y * x21; x51 -= l5.z * x22; x51 -= l5.w * x23; } __builtin_amdgcn_sched_barrier(0); { const v4f l6 = GDN_L4(51, 6); const v4f l7 = GDN_L4(51, 7); const v4f l8 = GDN_L4(51, 8); const v4f l9 = GDN_L4(51, 9); const v4f l10 = GDN_L4(51, 10); const v4f l11 = GDN_L4(51, 11); __builtin_amdgcn_sched_barrier(0); x51 -= l6.x * x24; x51 -= l6.y * x25; x51 -= l6.z * x26; x51 -= l6.w * x27; x51 -= l7.x * x28; x51 -= l7.y * x29; x51 -= l7.z * x30; x51 -= l7.w * x31; x51 -= l8.x * x32; x51 -= l8.y * x33; x51 -= l8.z * x34; x51 -= l8.w * x35; x51 -= l9.x * x36; x51 -= l9.y * x37; x51 -= l9.z * x38; x51 -= l9.w * x39; x51 -= l10.x * x40; x51 -= l10.y * x41; x51 -= l10.z * x42; x51 -= l10.w * x43; x51 -= l11.x * x44; x51 -= l11.y * x45; x51 -= l11.z * x46; x51 -= l11.w * x47; } __builtin_amdgcn_sched_barrier(0); { const v4f l12 = GDN_L4(51, 12); __builtin_amdgcn_sched_barrier(0); x51 -= l12.x * x48; x51 -= l12.y * x49; x51 -= l12.z * x50; } __builtin_amdgcn_sched_barrier(0);
        float x52 = GDN_RHS(52); { const v4f l0 = GDN_L4(52, 0); const v4f l1 = GDN_L4(52, 1); const v4f l2 = GDN_L4(52, 2); const v4f l3 = GDN_L4(52, 3); const v4f l4 = GDN_L4(52, 4); const v4f l5 = GDN_L4(52, 5); __builtin_amdgcn_sched_barrier(0); x52 -= l0.x * x0; x52 -= l0.y * x1; x52 -= l0.z * x2; x52 -= l0.w * x3; x52 -= l1.x * x4; x52 -= l1.y * x5; x52 -= l1.z * x6; x52 -= l1.w * x7; x52 -= l2.x * x8; x52 -= l2.y * x9; x52 -= l2.z * x10; x52 -= l2.w * x11; x52 -= l3.x * x12; x52 -= l3.y * x13; x52 -= l3.z * x14; x52 -= l3.w * x15; x52 -= l4.x * x16; x52 -= l4.y * x17; x52 -= l4.z * x18; x52 -= l4.w * x19; x52 -= l5.x * x20; x52 -= l5.y * x21; x52 -= l5.z * x22; x52 -= l5.w * x23; } __builtin_amdgcn_sched_barrier(0); { const v4f l6 = GDN_L4(52, 6); const v4f l7 = GDN_L4(52, 7); const v4f l8 = GDN_L4(52, 8); const v4f l9 = GDN_L4(52, 9); const v4f l10 = GDN_L4(52, 10); const v4f l11 = GDN_L4(52, 11); __builtin_amdgcn_sched_barrier(0); x52 -= l6.x * x24; x52 -= l6.y * x25; x52 -= l6.z * x26; x52 -= l6.w * x27; x52 -= l7.x * x28; x52 -= l7.y * x29; x52 -= l7.z * x30; x52 -= l7.w * x31; x52 -= l8.x * x32; x52 -= l8.y * x33; x52 -= l8.z * x34; x52 -= l8.w * x35; x52 -= l9.x * x36; x52 -= l9.y * x37; x52 -= l9.z * x38; x52 -= l9.w * x39; x52 -= l10.x * x40; x52 -= l10.y * x41; x52 -= l10.z * x42; x52 -= l10.w * x43; x52 -= l11.x * x44; x52 -= l11.y * x45; x52 -= l11.z * x46; x52 -= l11.w * x47; } __builtin_amdgcn_sched_barrier(0); { const v4f l12 = GDN_L4(52, 12); __builtin_amdgcn_sched_barrier(0); x52 -= l12.x * x48; x52 -= l12.y * x49; x52 -= l12.z * x50; x52 -= l12.w * x51; } __builtin_amdgcn_sched_barrier(0);
        float x53 = GDN_RHS(53); { const v4f l0 = GDN_L4(53, 0); const v4f l1 = GDN_L4(53, 1); const v4f l2 = GDN_L4(53, 2); const v4f l3 = GDN_L4(53, 3); const v4f l4 = GDN_L4(53, 4); const v4f l5 = GDN_L4(53, 5); __builtin_amdgcn_sched_barrier(0); x53 -= l0.x * x0; x53 -= l0.y * x1; x53 -= l0.z * x2; x53 -= l0.w * x3; x53 -= l1.x * x4; x53 -= l1.y * x5; x53 -= l1.z * x6; x53 -= l1.w * x7; x53 -= l2.x * x8; x53 -= l2.y * x9; x53 -= l2.z * x10; x53 -= l2.w * x11; x53 -= l3.x * x12; x53 -= l3.y * x13; x53 -= l3.z * x14; x53 -= l3.w * x15; x53 -= l4.x * x16; x53 -= l4.y * x17; x53 -= l4.z * x18; x53 -= l4.w * x19; x53 -= l5.x * x20; x53 -= l5.y * x21; x53 -= l5.z * x22; x53 -= l5.w * x23; } __builtin_amdgcn_sched_barrier(0); { const v4f l6 = GDN_L4(53, 6); const v4f l7 = GDN_L4(53, 7); const v4f l8 = GDN_L4(53, 8); const v4f l9 = GDN_L4(53, 9); const v4f l10 = GDN_L4(53, 10); const v4f l11 = GDN_L4(53, 11); __builtin_amdgcn_sched_barrier(0); x53 -= l6.x * x24; x53 -= l6.y * x25; x53 -= l6.z * x26; x53 -= l6.w * x27; x53 -= l7.x * x28; x53 -= l7.y * x29; x53 -= l7.z * x30; x53 -= l7.w * x31; x53 -= l8.x * x32; x53 -= l8.y * x33; x53 -= l8.z * x34; x53 -= l8.w * x35; x53 -= l9.x * x36; x53 -= l9.y * x37; x53 -= l9.z * x38; x53 -= l9.w * x39; x53 -= l10.x * x40; x53 -= l10.y * x41; x53 -= l10.z * x42; x53 -= l10.w * x43; x53 -= l11.x * x44; x53 -= l11.y * x45; x53 -= l11.z * x46; x53 -= l11.w * x47; } __builtin_amdgcn_sched_barrier(0); { const v4f l12 = GDN_L4(53, 12); const v4f l13 = GDN_L4(53, 13); __builtin_amdgcn_sched_barrier(0); x53 -= l12.x * x48; x53 -= l12.y * x49; x53 -= l12.z * x50; x53 -= l12.w * x51; x53 -= l13.x * x52; } __builtin_amdgcn_sched_barrier(0);
        float x54 = GDN_RHS(54); { const v4f l0 = GDN_L4(54, 0); const v4f l1 = GDN_L4(54, 1); const v4f l2 = GDN_L4(54, 2); const v4f l3 = GDN_L4(54, 3); const v4f l4 = GDN_L4(54, 4); const v4f l5 = GDN_L4(54, 5); __builtin_amdgcn_sched_barrier(0); x54 -= l0.x * x0; x54 -= l0.y * x1; x54 -= l0.z * x2; x54 -= l0.w * x3; x54 -= l1.x * x4; x54 -= l1.y * x5; x54 -= l1.z * x6; x54 -= l1.w * x7; x54 -= l2.x * x8; x54 -= l2.y * x9; x54 -= l2.z * x10; x54 -= l2.w * x11; x54 -= l3.x * x12; x54 -= l3.y * x13; x54 -= l3.z * x14; x54 -= l3.w * x15; x54 -= l4.x * x16; x54 -= l4.y * x17; x54 -= l4.z * x18; x54 -= l4.w * x19; x54 -= l5.x * x20; x54 -= l5.y * x21; x54 -= l5.z * x22; x54 -= l5.w * x23; } __builtin_amdgcn_sched_barrier(0); { const v4f l6 = GDN_L4(54, 6); const v4f l7 = GDN_L4(54, 7); const v4f l8 = GDN_L4(54, 8); const v4f l9 = GDN_L4(54, 9); const v4f l10 = GDN_L4(54, 10); const v4f l11 = GDN_L4(54, 11); __builtin_amdgcn_sched_barrier(0); x54 -= l6.x * x24; x54 -= l6.y * x25; x54 -= l6.z * x26; x54 -= l6.w * x27; x54 -= l7.x * x28; x54 -= l7.y * x29; x54 -= l7.z * x30; x54 -= l7.w * x31; x54 -= l8.x * x32; x54 -= l8.y * x33; x54 -= l8.z * x34; x54 -= l8.w * x35; x54 -= l9.x * x36; x54 -= l9.y * x37; x54 -= l9.z * x38; x54 -= l9.w * x39; x54 -= l10.x * x40; x54 -= l10.y * x41; x54 -= l10.z * x42; x54 -= l10.w * x43; x54 -= l11.x * x44; x54 -= l11.y * x45; x54 -= l11.z * x46; x54 -= l11.w * x47; } __builtin_amdgcn_sched_barrier(0); { const v4f l12 = GDN_L4(54, 12); const v4f l13 = GDN_L4(54, 13); __builtin_amdgcn_sched_barrier(0); x54 -= l12.x * x48; x54 -= l12.y * x49; x54 -= l12.z * x50; x54 -= l12.w * x51; x54 -= l13.x * x52; x54 -= l13.y * x53; } __builtin_amdgcn_sched_barrier(0);
        float x55 = GDN_RHS(55); { const v4f l0 = GDN_L4(55, 0); const v4f l1 = GDN_L4(55, 1); const v4f l2 = GDN_L4(55, 2); const v4f l3 = GDN_L4(55, 3); const v4f l4 = GDN_L4(55, 4); const v4f l5 = GDN_L4(55, 5); __builtin_amdgcn_sched_barrier(0); x55 -= l0.x * x0; x55 -= l0.y * x1; x55 -= l0.z * x2; x55 -= l0.w * x3; x55 -= l1.x * x4; x55 -= l1.y * x5; x55 -= l1.z * x6; x55 -= l1.w * x7; x55 -= l2.x * x8; x55 -= l2.y * x9; x55 -= l2.z * x10; x55 -= l2.w * x11; x55 -= l3.x * x12; x55 -= l3.y * x13; x55 -= l3.z * x14; x55 -= l3.w * x15; x55 -= l4.x * x16; x55 -= l4.y * x17; x55 -= l4.z * x18; x55 -= l4.w * x19; x55 -= l5.x * x20; x55 -= l5.y * x21; x55 -= l5.z * x22; x55 -= l5.w * x23; } __builtin_amdgcn_sched_barrier(0); { const v4f l6 = GDN_L4(55, 6); const v4f l7 = GDN_L4(55, 7); const v4f l8 = GDN_L4(55, 8); const v4f l9 = GDN_L4(55, 9); const v4f l10 = GDN_L4(55, 10); const v4f l11 = GDN_L4(55, 11); __builtin_amdgcn_sched_barrier(0); x55 -= l6.x * x24; x55 -= l6.y * x25; x55 -= l6.z * x26; x55 -= l6.w * x27; x55 -= l7.x * x28; x55 -= l7.y * x29; x55 -= l7.z * x30; x55 -= l7.w * x31; x55 -= l8.x * x32; x55 -= l8.y * x33; x55 -= l8.z * x34; x55 -= l8.w * x35; x55 -= l9.x * x36; x55 -= l9.y * x37; x55 -= l9.z * x38; x55 -= l9.w * x39; x55 -= l10.x * x40; x55 -= l10.y * x41; x55 -= l10.z * x42; x55 -= l10.w * x43; x55 -= l11.x * x44; x55 -= l11.y * x45; x55 -= l11.z * x46; x55 -= l11.w * x47; } __builtin_amdgcn_sched_barrier(0); { const v4f l12 = GDN_L4(55, 12); const v4f l13 = GDN_L4(55, 13); __builtin_amdgcn_sched_barrier(0); x55 -= l12.x * x48; x55 -= l12.y * x49; x55 -= l12.z * x50; x55 -= l12.w * x51; x55 -= l13.x * x52; x55 -= l13.y * x53; x55 -= l13.z * x54; } __builtin_amdgcn_sched_barrier(0);
        float x56 = GDN_RHS(56); { const v4f l0 = GDN_L4(56, 0); const v4f l1 = GDN_L4(56, 1); const v4f l2 = GDN_L4(56, 2); const v4f l3 = GDN_L4(56, 3); const v4f l4 = GDN_L4(56, 4); const v4f l5 = GDN_L4(56, 5); __builtin_amdgcn_sched_barrier(0); x56 -= l0.x * x0; x56 -= l0.y * x1; x56 -= l0.z * x2; x56 -= l0.w * x3; x56 -= l1.x * x4; x56 -= l1.y * x5; x56 -= l1.z * x6; x56 -= l1.w * x7; x56 -= l2.x * x8; x56 -= l2.y * x9; x56 -= l2.z * x10; x56 -= l2.w * x11; x56 -= l3.x * x12; x56 -= l3.y * x13; x56 -= l3.z * x14; x56 -= l3.w * x15; x56 -= l4.x * x16; x56 -= l4.y * x17; x56 -= l4.z * x18; x56 -= l4.w * x19; x56 -= l5.x * x20; x56 -= l5.y * x21; x56 -= l5.z * x22; x56 -= l5.w * x23; } __builtin_amdgcn_sched_barrier(0); { const v4f l6 = GDN_L4(56, 6); const v4f l7 = GDN_L4(56, 7); const v4f l8 = GDN_L4(56, 8); const v4f l9 = GDN_L4(56, 9); const v4f l10 = GDN_L4(56, 10); const v4f l11 = GDN_L4(56, 11); __builtin_amdgcn_sched_barrier(0); x56 -= l6.x * x24; x56 -= l6.y * x25; x56 -= l6.z * x26; x56 -= l6.w * x27; x56 -= l7.x * x28; x56 -= l7.y * x29; x56 -= l7.z * x30; x56 -= l7.w * x31; x56 -= l8.x * x32; x56 -= l8.y * x33; x56 -= l8.z * x34; x56 -= l8.w * x35; x56 -= l9.x * x36; x56 -= l9.y * x37; x56 -= l9.z * x38; x56 -= l9.w * x39; x56 -= l10.x * x40; x56 -= l10.y * x41; x56 -= l10.z * x42; x56 -= l10.w * x43; x56 -= l11.x * x44; x56 -= l11.y * x45; x56 -= l11.z * x46; x56 -= l11.w * x47; } __builtin_amdgcn_sched_barrier(0); { const v4f l12 = GDN_L4(56, 12); const v4f l13 = GDN_L4(56, 13); __builtin_amdgcn_sched_barrier(0); x56 -= l12.x * x48; x56 -= l12.y * x49; x56 -= l12.z * x50; x56 -= l12.w * x51; x56 -= l13.x * x52; x56 -= l13.y * x53; x56 -= l13.z * x54; x56 -= l13.w * x55; } __builtin_amdgcn_sched_barrier(0);
        float x57 = GDN_RHS(57); { const v4f l0 = GDN_L4(57, 0); const v4f l1 = GDN_L4(57, 1); const v4f l2 = GDN_L4(57, 2); const v4f l3 = GDN_L4(57, 3); const v4f l4 = GDN_L4(57, 4); const v4f l5 = GDN_L4(57, 5); __builtin_amdgcn_sched_barrier(0); x57 -= l0.x * x0; x57 -= l0.y * x1; x57 -= l0.z * x2; x57 -= l0.w * x3; x57 -= l1.x * x4; x57 -= l1.y * x5; x57 -= l1.z * x6; x57 -= l1.w * x7; x57 -= l2.x * x8; x57 -= l2.y * x9; x57 -= l2.z * x10; x57 -= l2.w * x11; x57 -= l3.x * x12; x57 -= l3.y * x13; x57 -= l3.z * x14; x57 -= l3.w * x15; x57 -= l4.x * x16; x57 -= l4.y * x17; x57 -= l4.z * x18; x57 -= l4.w * x19; x57 -= l5.x * x20; x57 -= l5.y * x21; x57 -= l5.z * x22; x57 -= l5.w * x23; } __builtin_amdgcn_sched_barrier(0); { const v4f l6 = GDN_L4(57, 6); const v4f l7 = GDN_L4(57, 7); const v4f l8 = GDN_L4(57, 8); const v4f l9 = GDN_L4(57, 9); const v4f l10 = GDN_L4(57, 10); const v4f l11 = GDN_L4(57, 11); __builtin_amdgcn_sched_barrier(0); x57 -= l6.x * x24; x57 -= l6.y * x25; x57 -= l6.z * x26; x57 -= l6.w * x27; x57 -= l7.x * x28; x57 -= l7.y * x29; x57 -= l7.z * x30; x57 -= l7.w * x31; x57 -= l8.x * x32; x57 -= l8.y * x33; x57 -= l8.z * x34; x57 -= l8.w * x35; x57 -= l9.x * x36; x57 -= l9.y * x37; x57 -= l9.z * x38; x57 -= l9.w * x39; x57 -= l10.x * x40; x57 -= l10.y * x41; x57 -= l10.z * x42; x57 -= l10.w * x43; x57 -= l11.x * x44; x57 -= l11.y * x45; x57 -= l11.z * x46; x57 -= l11.w * x47; } __builtin_amdgcn_sched_barrier(0); { const v4f l12 = GDN_L4(57, 12); const v4f l13 = GDN_L4(57, 13); const v4f l14 = GDN_L4(57, 14); __builtin_amdgcn_sched_barrier(0); x57 -= l12.x * x48; x57 -= l12.y * x49; x57 -= l12.z * x50; x57 -= l12.w * x51; x57 -= l13.x * x52; x57 -= l13.y * x53; x57 -= l13.z * x54; x57 -= l13.w * x55; x57 -= l14.x * x56; } __builtin_amdgcn_sched_barrier(0);
        float x58 = GDN_RHS(58); { const v4f l0 = GDN_L4(58, 0); const v4f l1 = GDN_L4(58, 1); const v4f l2 = GDN_L4(58, 2); const v4f l3 = GDN_L4(58, 3); const v4f l4 = GDN_L4(58, 4); const v4f l5 = GDN_L4(58, 5); __builtin_amdgcn_sched_barrier(0); x58 -= l0.x * x0; x58 -= l0.y * x1; x58 -= l0.z * x2; x58 -= l0.w * x3; x58 -= l1.x * x4; x58 -= l1.y * x5; x58 -= l1.z * x6; x58 -= l1.w * x7; x58 -= l2.x * x8; x58 -= l2.y * x9; x58 -= l2.z * x10; x58 -= l2.w * x11; x58 -= l3.x * x12; x58 -= l3.y * x13; x58 -= l3.z * x14; x58 -= l3.w * x15; x58 -= l4.x * x16; x58 -= l4.y * x17; x58 -= l4.z * x18; x58 -= l4.w * x19; x58 -= l5.x * x20; x58 -= l5.y * x21; x58 -= l5.z * x22; x58 -= l5.w * x23; } __builtin_amdgcn_sched_barrier(0); { const v4f l6 = GDN_L4(58, 6); const v4f l7 = GDN_L4(58, 7); const v4f l8 = GDN_L4(58, 8); const v4f l9 = GDN_L4(58, 9); const v4f l10 = GDN_L4(58, 10); const v4f l11 = GDN_L4(58, 11); __builtin_amdgcn_sched_barrier(0); x58 -= l6.x * x24; x58 -= l6.y * x25; x58 -= l6.z * x26; x58 -= l6.w * x27; x58 -= l7.x * x28; x58 -= l7.y * x29; x58 -= l7.z * x30; x58 -= l7.w * x31; x58 -= l8.x * x32; x58 -= l8.y * x33; x58 -= l8.z * x34; x58 -= l8.w * x35; x58 -= l9.x * x36; x58 -= l9.y * x37; x58 -= l9.z * x38; x58 -= l9.w * x39; x58 -= l10.x * x40; x58 -= l10.y * x41; x58 -= l10.z * x42; x58 -= l10.w * x43; x58 -= l11.x * x44; x58 -= l11.y * x45; x58 -= l11.z * x46; x58 -= l11.w * x47; } __builtin_amdgcn_sched_barrier(0); { const v4f l12 = GDN_L4(58, 12); const v4f l13 = GDN_L4(58, 13); const v4f l14 = GDN_L4(58, 14); __builtin_amdgcn_sched_barrier(0); x58 -= l12.x * x48; x58 -= l12.y * x49; x58 -= l12.z * x50; x58 -= l12.w * x51; x58 -= l13.x * x52; x58 -= l13.y * x53; x58 -= l13.z * x54; x58 -= l13.w * x55; x58 -= l14.x * x56; x58 -= l14.y * x57; } __builtin_amdgcn_sched_barrier(0);
        float x59 = GDN_RHS(59); { const v4f l0 = GDN_L4(59, 0); const v4f l1 = GDN_L4(59, 1); const v4f l2 = GDN_L4(59, 2); const v4f l3 = GDN_L4(59, 3); const v4f l4 = GDN_L4(59, 4); const v4f l5 = GDN_L4(59, 5); __builtin_amdgcn_sched_barrier(0); x59 -= l0.x * x0; x59 -= l0.y * x1; x59 -= l0.z * x2; x59 -= l0.w * x3; x59 -= l1.x * x4; x59 -= l1.y * x5; x59 -= l1.z * x6; x59 -= l1.w * x7; x59 -= l2.x * x8; x59 -= l2.y * x9; x59 -= l2.z * x10; x59 -= l2.w * x11; x59 -= l3.x * x12; x59 -= l3.y * x13; x59 -= l3.z * x14; x59 -= l3.w * x15; x59 -= l4.x * x16; x59 -= l4.y * x17; x59 -= l4.z * x18; x59 -= l4.w * x19; x59 -= l5.x * x20; x59 -= l5.y * x21; x59 -= l5.z * x22; x59 -= l5.w * x23; } __builtin_amdgcn_sched_barrier(0); { const v4f l6 = GDN_L4(59, 6); const v4f l7 = GDN_L4(59, 7); const v4f l8 = GDN_L4(59, 8); const v4f l9 = GDN_L4(59, 9); const v4f l10 = GDN_L4(59, 10); const v4f l11 = GDN_L4(59, 11); __builtin_amdgcn_sched_barrier(0); x59 -= l6.x * x24; x59 -= l6.y * x25; x59 -= l6.z * x26; x59 -= l6.w * x27; x59 -= l7.x * x28; x59 -= l7.y * x29; x59 -= l7.z * x30; x59 -= l7.w * x31; x59 -= l8.x * x32; x59 -= l8.y * x33; x59 -= l8.z * x34; x59 -= l8.w * x35; x59 -= l9.x * x36; x59 -= l9.y * x37; x59 -= l9.z * x38; x59 -= l9.w * x39; x59 -= l10.x * x40; x59 -= l10.y * x41; x59 -= l10.z * x42; x59 -= l10.w * x43; x59 -= l11.x * x44; x59 -= l11.y * x45; x59 -= l11.z * x46; x59 -= l11.w * x47; } __builtin_amdgcn_sched_barrier(0); { const v4f l12 = GDN_L4(59, 12); const v4f l13 = GDN_L4(59, 13); const v4f l14 = GDN_L4(59, 14); __builtin_amdgcn_sched_barrier(0); x59 -= l12.x * x48; x59 -= l12.y * x49; x59 -= l12.z * x50; x59 -= l12.w * x51; x59 -= l13.x * x52; x59 -= l13.y * x53; x59 -= l13.z * x54; x59 -= l13.w * x55; x59 -= l14.x * x56; x59 -= l14.y * x57; x59 -= l14.z * x58; } __builtin_amdgcn_sched_barrier(0);
        float x60 = GDN_RHS(60); { const v4f l0 = GDN_L4(60, 0); const v4f l1 = GDN_L4(60, 1); const v4f l2 = GDN_L4(60, 2); const v4f l3 = GDN_L4(60, 3); const v4f l4 = GDN_L4(60, 4); const v4f l5 = GDN_L4(60, 5); __builtin_amdgcn_sched_barrier(0); x60 -= l0.x * x0; x60 -= l0.y * x1; x60 -= l0.z * x2; x60 -= l0.w * x3; x60 -= l1.x * x4; x60 -= l1.y * x5; x60 -= l1.z * x6; x60 -= l1.w * x7; x60 -= l2.x * x8; x60 -= l2.y * x9; x60 -= l2.z * x10; x60 -= l2.w * x11; x60 -= l3.x * x12; x60 -= l3.y * x13; x60 -= l3.z * x14; x60 -= l3.w * x15; x60 -= l4.x * x16; x60 -= l4.y * x17; x60 -= l4.z * x18; x60 -= l4.w * x19; x60 -= l5.x * x20; x60 -= l5.y * x21; x60 -= l5.z * x22; x60 -= l5.w * x23; } __builtin_amdgcn_sched_barrier(0); { const v4f l6 = GDN_L4(60, 6); const v4f l7 = GDN_L4(60, 7); const v4f l8 = GDN_L4(60, 8); const v4f l9 = GDN_L4(60, 9); const v4f l10 = GDN_L4(60, 10); const v4f l11 = GDN_L4(60, 11); __builtin_amdgcn_sched_barrier(0); x60 -= l6.x * x24; x60 -= l6.y * x25; x60 -= l6.z * x26; x60 -= l6.w * x27; x60 -= l7.x * x28; x60 -= l7.y * x29; x60 -= l7.z * x30; x60 -= l7.w * x31; x60 -= l8.x * x32; x60 -= l8.y * x33; x60 -= l8.z * x34; x60 -= l8.w * x35; x60 -= l9.x * x36; x60 -= l9.y * x37; x60 -= l9.z * x38; x60 -= l9.w * x39; x60 -= l10.x * x40; x60 -= l10.y * x41; x60 -= l10.z * x42; x60 -= l10.w * x43; x60 -= l11.x * x44; x60 -= l11.y * x45; x60 -= l11.z * x46; x60 -= l11.w * x47; } __builtin_amdgcn_sched_barrier(0); { const v4f l12 = GDN_L4(60, 12); const v4f l13 = GDN_L4(60, 13); const v4f l14 = GDN_L4(60, 14); __builtin_amdgcn_sched_barrier(0); x60 -= l12.x * x48; x60 -= l12.y * x49; x60 -= l12.z * x50; x60 -= l12.w * x51; x60 -= l13.x * x52; x60 -= l13.y * x53; x60 -= l13.z * x54; x60 -= l13.w * x55; x60 -= l14.x * x56; x60 -= l14.y * x57; x60 -= l14.z * x58; x60 -= l14.w * x59; } __builtin_amdgcn_sched_barrier(0);
        float x61 = GDN_RHS(61); { const v4f l0 = GDN_L4(61, 0); const v4f l1 = GDN_L4(61, 1); const v4f l2 = GDN_L4(61, 2); const v4f l3 = GDN_L4(61, 3); const v4f l4 = GDN_L4(61, 4); const v4f l5 = GDN_L4(61, 5); __builtin_amdgcn_sched_barrier(0); x61 -= l0.x * x0; x61 -= l0.y * x1; x61 -= l0.z * x2; x61 -= l0.w * x3; x61 -= l1.x * x4; x61 -= l1.y * x5; x61 -= l1.z * x6; x61 -= l1.w * x7; x61 -= l2.x * x8; x61 -= l2.y * x9; x61 -= l2.z * x10; x61 -= l2.w * x11; x61 -= l3.x * x12; x61 -= l3.y * x13; x61 -= l3.z * x14; x61 -= l3.w * x15; x61 -= l4.x * x16; x61 -= l4.y * x17; x61 -= l4.z * x18; x61 -= l4.w * x19; x61 -= l5.x * x20; x61 -= l5.y * x21; x61 -= l5.z * x22; x61 -= l5.w * x23; } __builtin_amdgcn_sched_barrier(0); { const v4f l6 = GDN_L4(61, 6); const v4f l7 = GDN_L4(61, 7); const v4f l8 = GDN_L4(61, 8); const v4f l9 = GDN_L4(61, 9); const v4f l10 = GDN_L4(61, 10); const v4f l11 = GDN_L4(61, 11); __builtin_amdgcn_sched_barrier(0); x61 -= l6.x * x24; x61 -= l6.y * x25; x61 -= l6.z * x26; x61 -= l6.w * x27; x61 -= l7.x * x28; x61 -= l7.y * x29; x61 -= l7.z * x30; x61 -= l7.w * x31; x61 -= l8.x * x32; x61 -= l8.y * x33; x61 -= l8.z * x34; x61 -= l8.w * x35; x61 -= l9.x * x36; x61 -= l9.y * x37; x61 -= l9.z * x38; x61 -= l9.w * x39; x61 -= l10.x * x40; x61 -= l10.y * x41; x61 -= l10.z * x42; x61 -= l10.w * x43; x61 -= l11.x * x44; x61 -= l11.y * x45; x61 -= l11.z * x46; x61 -= l11.w * x47; } __builtin_amdgcn_sched_barrier(0); { const v4f l12 = GDN_L4(61, 12); const v4f l13 = GDN_L4(61, 13); const v4f l14 = GDN_L4(61, 14); const v4f l15 = GDN_L4(61, 15); __builtin_amdgcn_sched_barrier(0); x61 -= l12.x * x48; x61 -= l12.y * x49; x61 -= l12.z * x50; x61 -= l12.w * x51; x61 -= l13.x * x52; x61 -= l13.y * x53; x61 -= l13.z * x54; x61 -= l13.w * x55; x61 -= l14.x * x56; x61 -= l14.y * x57; x61 -= l14.z * x58; x61 -= l14.w * x59; x61 -= l15.x * x60; } __builtin_amdgcn_sched_barrier(0);
        float x62 = GDN_RHS(62); { const v4f l0 = GDN_L4(62, 0); const v4f l1 = GDN_L4(62, 1); const v4f l2 = GDN_L4(62, 2); const v4f l3 = GDN_L4(62, 3); const v4f l4 = GDN_L4(62, 4); const v4f l5 = GDN_L4(62, 5); __builtin_amdgcn_sched_barrier(0); x62 -= l0.x * x0; x62 -= l0.y * x1; x62 -= l0.z * x2; x62 -= l0.w * x3; x62 -= l1.x * x4; x62 -= l1.y * x5; x62 -= l1.z * x6; x62 -= l1.w * x7; x62 -= l2.x * x8; x62 -= l2.y * x9; x62 -= l2.z * x10; x62 -= l2.w * x11; x62 -= l3.x * x12; x62 -= l3.y * x13; x62 -= l3.z * x14; x62 -= l3.w * x15; x62 -= l4.x * x16; x62 -= l4.y * x17; x62 -= l4.z * x18; x62 -= l4.w * x19; x62 -= l5.x * x20; x62 -= l5.y * x21; x62 -= l5.z * x22; x62 -= l5.w * x23; } __builtin_amdgcn_sched_barrier(0); { const v4f l6 = GDN_L4(62, 6); const v4f l7 = GDN_L4(62, 7); const v4f l8 = GDN_L4(62, 8); const v4f l9 = GDN_L4(62, 9); const v4f l10 = GDN_L4(62, 10); const v4f l11 = GDN_L4(62, 11); __builtin_amdgcn_sched_barrier(0); x62 -= l6.x * x24; x62 -= l6.y * x25; x62 -= l6.z * x26; x62 -= l6.w * x27; x62 -= l7.x * x28; x62 -= l7.y * x29; x62 -= l7.z * x30; x62 -= l7.w * x31; x62 -= l8.x * x32; x62 -= l8.y * x33; x62 -= l8.z * x34; x62 -= l8.w * x35; x62 -= l9.x * x36; x62 -= l9.y * x37; x62 -= l9.z * x38; x62 -= l9.w * x39; x62 -= l10.x * x40; x62 -= l10.y * x41; x62 -= l10.z * x42; x62 -= l10.w * x43; x62 -= l11.x * x44; x62 -= l11.y * x45; x62 -= l11.z * x46; x62 -= l11.w * x47; } __builtin_amdgcn_sched_barrier(0); { const v4f l12 = GDN_L4(62, 12); const v4f l13 = GDN_L4(62, 13); const v4f l14 = GDN_L4(62, 14); const v4f l15 = GDN_L4(62, 15); __builtin_amdgcn_sched_barrier(0); x62 -= l12.x * x48; x62 -= l12.y * x49; x62 -= l12.z * x50; x62 -= l12.w * x51; x62 -= l13.x * x52; x62 -= l13.y * x53; x62 -= l13.z * x54; x62 -= l13.w * x55; x62 -= l14.x * x56; x62 -= l14.y * x57; x62 -= l14.z * x58; x62 -= l14.w * x59; x62 -= l15.x * x60; x62 -= l15.y * x61; } __builtin_amdgcn_sched_barrier(0);
        float x63 = GDN_RHS(63); { const v4f l0 = GDN_L4(63, 0); const v4f l1 = GDN_L4(63, 1); const v4f l2 = GDN_L4(63, 2); const v4f l3 = GDN_L4(63, 3); const v4f l4 = GDN_L4(63, 4); const v4f l5 = GDN_L4(63, 5); __builtin_amdgcn_sched_barrier(0); x63 -= l0.x * x0; x63 -= l0.y * x1; x63 -= l0.z * x2; x63 -= l0.w * x3; x63 -= l1.x * x4; x63 -= l1.y * x5; x63 -= l1.z * x6; x63 -= l1.w * x7; x63 -= l2.x * x8; x63 -= l2.y * x9; x63 -= l2.z * x10; x63 -= l2.w * x11; x63 -= l3.x * x12; x63 -= l3.y * x13; x63 -= l3.z * x14; x63 -= l3.w * x15; x63 -= l4.x * x16; x63 -= l4.y * x17; x63 -= l4.z * x18; x63 -= l4.w * x19; x63 -= l5.x * x20; x63 -= l5.y * x21; x63 -= l5.z * x22; x63 -= l5.w * x23; } __builtin_amdgcn_sched_barrier(0); { const v4f l6 = GDN_L4(63, 6); const v4f l7 = GDN_L4(63, 7); const v4f l8 = GDN_L4(63, 8); const v4f l9 = GDN_L4(63, 9); const v4f l10 = GDN_L4(63, 10); const v4f l11 = GDN_L4(63, 11); __builtin_amdgcn_sched_barrier(0); x63 -= l6.x * x24; x63 -= l6.y * x25; x63 -= l6.z * x26; x63 -= l6.w * x27; x63 -= l7.x * x28; x63 -= l7.y * x29; x63 -= l7.z * x30; x63 -= l7.w * x31; x63 -= l8.x * x32; x63 -= l8.y * x33; x63 -= l8.z * x34; x63 -= l8.w * x35; x63 -= l9.x * x36; x63 -= l9.y * x37; x63 -= l9.z * x38; x63 -= l9.w * x39; x63 -= l10.x * x40; x63 -= l10.y * x41; x63 -= l10.z * x42; x63 -= l10.w * x43; x63 -= l11.x * x44; x63 -= l11.y * x45; x63 -= l11.z * x46; x63 -= l11.w * x47; } __builtin_amdgcn_sched_barrier(0); { const v4f l12 = GDN_L4(63, 12); const v4f l13 = GDN_L4(63, 13); const v4f l14 = GDN_L4(63, 14); const v4f l15 = GDN_L4(63, 15); __builtin_amdgcn_sched_barrier(0); x63 -= l12.x * x48; x63 -= l12.y * x49; x63 -= l12.z * x50; x63 -= l12.w * x51; x63 -= l13.x * x52; x63 -= l13.y * x53; x63 -= l13.z * x54; x63 -= l13.w * x55; x63 -= l14.x * x56; x63 -= l14.y * x57; x63 -= l14.z * x58; x63 -= l14.w * x59; x63 -= l15.x * x60; x63 -= l15.y * x61; x63 -= l15.z * x62; } __builtin_amdgcn_sched_barrier(0);
        if (c < 128) { GU[0 * 128 + c] = x0; GU[1 * 128 + c] = x1; GU[2 * 128 + c] = x2; GU[3 * 128 + c] = x3; GU[4 * 128 + c] = x4; GU[5 * 128 + c] = x5; GU[6 * 128 + c] = x6; GU[7 * 128 + c] = x7; GU[8 * 128 + c] = x8; GU[9 * 128 + c] = x9; GU[10 * 128 + c] = x10; GU[11 * 128 + c] = x11; GU[12 * 128 + c] = x12; GU[13 * 128 + c] = x13; GU[14 * 128 + c] = x14; GU[15 * 128 + c] = x15; GU[16 * 128 + c] = x16; GU[17 * 128 + c] = x17; GU[18 * 128 + c] = x18; GU[19 * 128 + c] = x19; GU[20 * 128 + c] = x20; GU[21 * 128 + c] = x21; GU[22 * 128 + c] = x22; GU[23 * 128 + c] = x23; GU[24 * 128 + c] = x24; GU[25 * 128 + c] = x25; GU[26 * 128 + c] = x26; GU[27 * 128 + c] = x27; GU[28 * 128 + c] = x28; GU[29 * 128 + c] = x29; GU[30 * 128 + c] = x30; GU[31 * 128 + c] = x31; GU[32 * 128 + c] = x32; GU[33 * 128 + c] = x33; GU[34 * 128 + c] = x34; GU[35 * 128 + c] = x35; GU[36 * 128 + c] = x36; GU[37 * 128 + c] = x37; GU[38 * 128 + c] = x38; GU[39 * 128 + c] = x39; GU[40 * 128 + c] = x40; GU[41 * 128 + c] = x41; GU[42 * 128 + c] = x42; GU[43 * 128 + c] = x43; GU[44 * 128 + c] = x44; GU[45 * 128 + c] = x45; GU[46 * 128 + c] = x46; GU[47 * 128 + c] = x47; GU[48 * 128 + c] = x48; GU[49 * 128 + c] = x49; GU[50 * 128 + c] = x50; GU[51 * 128 + c] = x51; GU[52 * 128 + c] = x52; GU[53 * 128 + c] = x53; GU[54 * 128 + c] = x54; GU[55 * 128 + c] = x55; GU[56 * 128 + c] = x56; GU[57 * 128 + c] = x57; GU[58 * 128 + c] = x58; GU[59 * 128 + c] = x59; GU[60 * 128 + c] = x60; GU[61 * 128 + c] = x61; GU[62 * 128 + c] = x62; GU[63 * 128 + c] = x63; }
        else { GNW[0 * 128 + (c - 128)] = (bf16)f2bf(-x0); GNW[1 * 128 + (c - 128)] = (bf16)f2bf(-x1); GNW[2 * 128 + (c - 128)] = (bf16)f2bf(-x2); GNW[3 * 128 + (c - 128)] = (bf16)f2bf(-x3); GNW[4 * 128 + (c - 128)] = (bf16)f2bf(-x4); GNW[5 * 128 + (c - 128)] = (bf16)f2bf(-x5); GNW[6 * 128 + (c - 128)] = (bf16)f2bf(-x6); GNW[7 * 128 + (c - 128)] = (bf16)f2bf(-x7); GNW[8 * 128 + (c - 128)] = (bf16)f2bf(-x8); GNW[9 * 128 + (c - 128)] = (bf16)f2bf(-x9); GNW[10 * 128 + (c - 128)] = (bf16)f2bf(-x10); GNW[11 * 128 + (c - 128)] = (bf16)f2bf(-x11); GNW[12 * 128 + (c - 128)] = (bf16)f2bf(-x12); GNW[13 * 128 + (c - 128)] = (bf16)f2bf(-x13); GNW[14 * 128 + (c - 128)] = (bf16)f2bf(-x14); GNW[15 * 128 + (c - 128)] = (bf16)f2bf(-x15); GNW[16 * 128 + (c - 128)] = (bf16)f2bf(-x16); GNW[17 * 128 + (c - 128)] = (bf16)f2bf(-x17); GNW[18 * 128 + (c - 128)] = (bf16)f2bf(-x18); GNW[19 * 128 + (c - 128)] = (bf16)f2bf(-x19); GNW[20 * 128 + (c - 128)] = (bf16)f2bf(-x20); GNW[21 * 128 + (c - 128)] = (bf16)f2bf(-x21); GNW[22 * 128 + (c - 128)] = (bf16)f2bf(-x22); GNW[23 * 128 + (c - 128)] = (bf16)f2bf(-x23); GNW[24 * 128 + (c - 128)] = (bf16)f2bf(-x24); GNW[25 * 128 + (c - 128)] = (bf16)f2bf(-x25); GNW[26 * 128 + (c - 128)] = (bf16)f2bf(-x26); GNW[27 * 128 + (c - 128)] = (bf16)f2bf(-x27); GNW[28 * 128 + (c - 128)] = (bf16)f2bf(-x28); GNW[29 * 128 + (c - 128)] = (bf16)f2bf(-x29); GNW[30 * 128 + (c - 128)] = (bf16)f2bf(-x30); GNW[31 * 128 + (c - 128)] = (bf16)f2bf(-x31); GNW[32 * 128 + (c - 128)] = (bf16)f2bf(-x32); GNW[33 * 128 + (c - 128)] = (bf16)f2bf(-x33); GNW[34 * 128 + (c - 128)] = (bf16)f2bf(-x34); GNW[35 * 128 + (c - 128)] = (bf16)f2bf(-x35); GNW[36 * 128 + (c - 128)] = (bf16)f2bf(-x36); GNW[37 * 128 + (c - 128)] = (bf16)f2bf(-x37); GNW[38 * 128 + (c - 128)] = (bf16)f2bf(-x38); GNW[39 * 128 + (c - 128)] = (bf16)f2bf(-x39); GNW[40 * 128 + (c - 128)] = (bf16)f2bf(-x40); GNW[41 * 128 + (c - 128)] = (bf16)f2bf(-x41); GNW[42 * 128 + (c - 128)] = (bf16)f2bf(-x42); GNW[43 * 128 + (c - 128)] = (bf16)f2bf(-x43); GNW[44 * 128 + (c - 128)] = (bf16)f2bf(-x44); GNW[45 * 128 + (c - 128)] = (bf16)f2bf(-x45); GNW[46 * 128 + (c - 128)] = (bf16)f2bf(-x46); GNW[47 * 128 + (c - 128)] = (bf16)f2bf(-x47); GNW[48 * 128 + (c - 128)] = (bf16)f2bf(-x48); GNW[49 * 128 + (c - 128)] = (bf16)f2bf(-x49); GNW[50 * 128 + (c - 128)] = (bf16)f2bf(-x50); GNW[51 * 128 + (c - 128)] = (bf16)f2bf(-x51); GNW[52 * 128 + (c - 128)] = (bf16)f2bf(-x52); GNW[53 * 128 + (c - 128)] = (bf16)f2bf(-x53); GNW[54 * 128 + (c - 128)] = (bf16)f2bf(-x54); GNW[55 * 128 + (c - 128)] = (bf16)f2bf(-x55); GNW[56 * 128 + (c - 128)] = (bf16)f2bf(-x56); GNW[57 * 128 + (c - 128)] = (bf16)f2bf(-x57); GNW[58 * 128 + (c - 128)] = (bf16)f2bf(-x58); GNW[59 * 128 + (c - 128)] = (bf16)f2bf(-x59); GNW[60 * 128 + (c - 128)] = (bf16)f2bf(-x60); GNW[61 * 128 + (c - 128)] = (bf16)f2bf(-x61); GNW[62 * 128 + (c - 128)] = (bf16)f2bf(-x62); GNW[63 * 128 + (c - 128)] = (bf16)f2bf(-x63); }
#undef GDN_RHS
#undef GDN_L4
    } else {
        const int t2 = tid - 256; const float gl = gcs[63];
        { const int i = t2 >> 2, d0 = (t2 & 3) * 32; const float e = __expf(gcs[i]);
#pragma unroll
          for (int x8 = 0; x8 < 4; ++x8) { const v4f a = *(const LAS v4f*)(qs + i * QP + d0 + 8 * x8), b = *(const LAS v4f*)(qs + i * QP + d0 + 8 * x8 + 4);
              v4u w; w.x = pk2(a.x * e, a.y * e); w.y = pk2(a.z * e, a.w * e); w.z = pk2(b.x * e, b.y * e); w.w = pk2(b.z * e, b.w * e); *(v4u*)(GQG + i * 128 + d0 + 8 * x8) = w; } }
        { const int d = t2 >> 1, j0 = (t2 & 1) * 32;
#pragma unroll
          for (int x8 = 0; x8 < 4; ++x8) { float o[8];
#pragma unroll
              for (int x = 0; x < 8; ++x) { const int j = j0 + 8 * x8 + x; o[x] = ks[j * QP + d] * __expf(gl - gcs[j]); }
              v4u w; w.x = pk2(o[0], o[1]); w.y = pk2(o[2], o[3]); w.z = pk2(o[4], o[5]); w.w = pk2(o[6], o[7]); *(v4u*)(GKT + d * 64 + j0 + 8 * x8) = w; } }
        if (t2 == 0) GDL[item] = __expf(gl);
    }
    __syncthreads();
}
struct GdnFrags { bf16x8_t nw[4], qg[4], at[2], kt[2][2]; float u[4]; float dl; };
__device__ __forceinline__ void gdn_load(GdnFrags& F, const Params& p, int item, int off128, int off64, int offk, int offu) {
    const bf16* GNW = (const bf16*)(p.ws + WS_GNW) + (size_t)item * 8192; const bf16* GQG = (const bf16*)(p.ws + WS_GQG) + (size_t)item * 8192;
    const bf16* GAT = (const bf16*)(p.ws + WS_GAT) + (size_t)item * 4096; const bf16* GKT = (const bf16*)(p.ws + WS_GKT) + (size_t)item * 8192; const float* GU = (const float*)(p.ws + WS_GU) + (size_t)item * 8192;
#pragma unroll
    for (int ks = 0; ks < 4; ++ks) { F.nw[ks] = *(const bf16x8_t*)(GNW + off128 + 32 * ks); F.qg[ks] = *(const bf16x8_t*)(GQG + off128 + 32 * ks); }
#pragma unroll
    for (int ks = 0; ks < 2; ++ks) { F.at[ks] = *(const bf16x8_t*)(GAT + off64 + 32 * ks); F.kt[0][ks] = *(const bf16x8_t*)(GKT + offk + 32 * ks); F.kt[1][ks] = *(const bf16x8_t*)(GKT + offk + 1024 + 32 * ks); }
#pragma unroll
    for (int r = 0; r < 4; ++r) F.u[r] = GU[offu + r * 128];
    F.dl = ((const float*)(p.ws + WS_GDL))[item];
}
constexpr int STP = 136, VNP = 72;
__device__ __forceinline__ void gdn_seq(const Params& p, LAS unsigned char* lds, int wgi, int wave, int lane) {
    const int u = wgi * 2 + (wave >> 2), wi = wave & 3, h = u >> 3, sl = u & 7, g = lane >> 4, c = lane & 15;
    LAS unsigned short* ST = (LAS unsigned short*)(lds + (wave >> 2) * 12288);
    LAS unsigned short* VNT = ST + 2 * 16 * STP;
    float* GO = (float*)(p.ws + WS_GO);
    const int off128 = (16 * wi + c) * 128 + 8 * g, off64 = (16 * wi + c) * 64 + 8 * g, offk = (32 * wi + c) * 64 + 8 * g, offu = (16 * wi + 4 * g) * 128 + 16 * sl + c;
#pragma unroll
    for (int mt = 0; mt < 2; ++mt) *(LAS v2u*)(ST + c * STP + 16 * (2 * wi + mt) + 4 * g) = (v2u){0u, 0u};
    pg8::f32x4 Sacc[2] = {{0.f, 0.f, 0.f, 0.f}, {0.f, 0.f, 0.f, 0.f}};
    __syncthreads();
    GdnFrags F0, F1;
    gdn_load(F0, p, h, off128, off64, offk, offu);
#define GDN_STEP(F, n_) do { const int cur = (n_) & 1; bf16x8_t sf[4]; \
        _Pragma("unroll") for (int ks = 0; ks < 4; ++ks) sf[ks] = *(const LAS bf16x8_t*)(ST + cur * 16 * STP + c * STP + 32 * ks + 8 * g); \
        pg8::f32x4 vn = {F.u[0], F.u[1], F.u[2], F.u[3]}; \
        _Pragma("unroll") for (int ks = 0; ks < 4; ++ks) vn = __builtin_amdgcn_mfma_f32_16x16x32_bf16(F.nw[ks], sf[ks], vn, 0, 0, 0); \
        { v2u w; w.x = pk2(vn[0], vn[1]); w.y = pk2(vn[2], vn[3]); *(LAS v2u*)(VNT + c * VNP + 16 * wi + 4 * g) = w; } \
        LDS_BAR(); \
        const bf16x8_t v0 = *(const LAS bf16x8_t*)(VNT + c * VNP + 8 * g), v1 = *(const LAS bf16x8_t*)(VNT + c * VNP + 32 + 8 * g); \
        pg8::f32x4 o = {0.f, 0.f, 0.f, 0.f}; \
        _Pragma("unroll") for (int ks = 0; ks < 4; ++ks) o = __builtin_amdgcn_mfma_f32_16x16x32_bf16(F.qg[ks], sf[ks], o, 0, 0, 0); \
        o = __builtin_amdgcn_mfma_f32_16x16x32_bf16(F.at[0], v0, o, 0, 0, 0); o = __builtin_amdgcn_mfma_f32_16x16x32_bf16(F.at[1], v1, o, 0, 0, 0); \
        { const size_t tb = (size_t)(n_) * 64 + 16 * wi + 4 * g; _Pragma("unroll") for (int r = 0; r < 4; ++r) GO[(tb + r) * BW + h * 128 + 16 * sl + c] = o[r]; } \
        _Pragma("unroll") for (int mt = 0; mt < 2; ++mt) { Sacc[mt] = Sacc[mt] * F.dl; \
            Sacc[mt] = __builtin_amdgcn_mfma_f32_16x16x32_bf16(F.kt[mt][0], v0, Sacc[mt], 0, 0, 0); Sacc[mt] = __builtin_amdgcn_mfma_f32_16x16x32_bf16(F.kt[mt][1], v1, Sacc[mt], 0, 0, 0); \
            v2u w; w.x = pk2(Sacc[mt][0], Sacc[mt][1]); w.y = pk2(Sacc[mt][2], Sacc[mt][3]); *(LAS v2u*)(ST + (cur ^ 1) * 16 * STP + c * STP + 16 * (2 * wi + mt) + 4 * g) = w; } \
        LDS_BAR(); } while (0)
    for (int n = 0; n < T / 64; n += 2) {
        gdn_load(F1, p, (n + 1) * 4 + h, off128, off64, offk, offu);
        GDN_STEP(F0, n);
        gdn_load(F0, p, ((n + 2 < T / 64) ? n + 2 : n) * 4 + h, off128, off64, offk, offu);
        GDN_STEP(F1, n + 1);
    }
#undef GDN_STEP
}

constexpr int SEQ_UOFF = 132096;
constexpr int GI_NW = 0, GI_QG = 8704, GI_AT = 17408, GI_KT = 22016, GI_SZ = 31232;
struct GdnStage { v4u r[7]; float u[4]; float dl; };
__device__ __forceinline__ void gdn_stage_load(GdnStage& Sg, const Params& p, int item, int tid, int offu) {
    const bf16* GNW = (const bf16*)(p.ws + WS_GNW) + (size_t)item * 8192; const bf16* GQG = (const bf16*)(p.ws + WS_GQG) + (size_t)item * 8192;
    const bf16* GAT = (const bf16*)(p.ws + WS_GAT) + (size_t)item * 4096; const bf16* GKT = (const bf16*)(p.ws + WS_GKT) + (size_t)item * 8192; const float* GU = (const float*)(p.ws + WS_GU) + (size_t)item * 8192;
    Sg.r[0] = *(const v4u*)(GNW + 8 * tid); Sg.r[1] = *(const v4u*)(GNW + 8 * (tid + 512)); Sg.r[2] = *(const v4u*)(GQG + 8 * tid); Sg.r[3] = *(const v4u*)(GQG + 8 * (tid + 512));
    Sg.r[4] = *(const v4u*)(GAT + 8 * tid); Sg.r[5] = *(const v4u*)(GKT + 8 * tid); Sg.r[6] = *(const v4u*)(GKT + 8 * (tid + 512));
#pragma unroll
    for (int r = 0; r < 4; ++r) Sg.u[r] = GU[offu + r * 128];
    Sg.dl = ((const float*)(p.ws + WS_GDL))[item];
}
__device__ __forceinline__ void gdn_stage_write(const GdnStage& Sg, LAS unsigned short* img, int tid) {
    { const int p0 = tid, p1 = tid + 512;
      *(LAS v4u*)(img + GI_NW + (p0 >> 4) * 136 + 8 * (p0 & 15)) = Sg.r[0]; *(LAS v4u*)(img + GI_NW + (p1 >> 4) * 136 + 8 * (p1 & 15)) = Sg.r[1];
      *(LAS v4u*)(img + GI_QG + (p0 >> 4) * 136 + 8 * (p0 & 15)) = Sg.r[2]; *(LAS v4u*)(img + GI_QG + (p1 >> 4) * 136 + 8 * (p1 & 15)) = Sg.r[3];
      *(LAS v4u*)(img + GI_AT + (p0 >> 3) * 72 + 8 * (p0 & 7)) = Sg.r[4];
      *(LAS v4u*)(img + GI_KT + (p0 >> 3) * 72 + 8 * (p0 & 7)) = Sg.r[5]; *(LAS v4u*)(img + GI_KT + (p1 >> 3) * 72 + 8 * (p1 & 7)) = Sg.r[6]; }
}
__device__ __forceinline__ void gdn_seq2(const Params& p, LAS unsigned char* lds, int wgi, int tid, int wave, int lane) {
    const int h = wgi >> 2, sl = 2 * (wgi & 3) + (wave >> 2), wi = wave & 3, g = lane >> 4, c = lane & 15;
    LAS unsigned short* IMG = (LAS unsigned short*)lds;
    LAS unsigned short* ST = (LAS unsigned short*)(lds + SEQ_UOFF + (wave >> 2) * 12288);
    LAS unsigned short* VNT = ST + 2 * 16 * STP;
    float* GO = (float*)(p.ws + WS_GO);
    const int offu = (16 * wi + 4 * g) * 128 + 16 * sl + c;
#pragma unroll
    for (int mt = 0; mt < 2; ++mt) *(LAS v2u*)(ST + c * STP + 16 * (2 * wi + mt) + 4 * g) = (v2u){0u, 0u};
    pg8::f32x4 Sacc[2] = {{0.f, 0.f, 0.f, 0.f}, {0.f, 0.f, 0.f, 0.f}};
    GdnStage A, B;
    gdn_stage_load(A, p, h, tid, offu); gdn_stage_write(A, IMG, tid);
    gdn_stage_load(B, p, 4 + h, tid, offu);
    LDS_BAR();
    constexpr int NCH = T / 64;
#define GDN_STEP2(X, Y, n_) do { const int cur = (n_) & 1; const LAS unsigned short* im = IMG + cur * GI_SZ; bf16x8_t sf[4]; \
        _Pragma("unroll") for (int ks = 0; ks < 4; ++ks) sf[ks] = *(const LAS bf16x8_t*)(ST + cur * 16 * STP + c * STP + 32 * ks + 8 * g); \
        pg8::f32x4 vn = {X.u[0], X.u[1], X.u[2], X.u[3]}; const float dl = X.dl; \
        _Pragma("unroll") for (int ks = 0; ks < 4; ++ks) vn = __builtin_amdgcn_mfma_f32_16x16x32_bf16(*(const LAS bf16x8_t*)(im + GI_NW + (16 * wi + c) * 136 + 32 * ks + 8 * g), sf[ks], vn, 0, 0, 0); \
        { v2u w; w.x = pk2(vn[0], vn[1]); w.y = pk2(vn[2], vn[3]); *(LAS v2u*)(VNT + c * VNP + 16 * wi + 4 * g) = w; } \
        pg8::f32x4 o = {0.f, 0.f, 0.f, 0.f}; \
        _Pragma("unroll") for (int ks = 0; ks < 4; ++ks) o = __builtin_amdgcn_mfma_f32_16x16x32_bf16(*(const LAS bf16x8_t*)(im + GI_QG + (16 * wi + c) * 136 + 32 * ks + 8 * g), sf[ks], o, 0, 0, 0); \
        LDS_BAR(); \
        gdn_stage_load(X, p, (((n_) + 2 < NCH) ? (n_) + 2 : (n_)) * 4 + h, tid, offu); \
        const bf16x8_t v0 = *(const LAS bf16x8_t*)(VNT + c * VNP + 8 * g), v1 = *(const LAS bf16x8_t*)(VNT + c * VNP + 32 + 8 * g); \
        o = __builtin_amdgcn_mfma_f32_16x16x32_bf16(*(const LAS bf16x8_t*)(im + GI_AT + (16 * wi + c) * 72 + 8 * g), v0, o, 0, 0, 0); \
        o = __builtin_amdgcn_mfma_f32_16x16x32_bf16(*(const LAS bf16x8_t*)(im + GI_AT + (16 * wi + c) * 72 + 32 + 8 * g), v1, o, 0, 0, 0); \
        { const size_t tb = (size_t)(n_) * 64 + 16 * wi + 4 * g; _Pragma("unroll") for (int r = 0; r < 4; ++r) GO[(tb + r) * BW + h * 128 + 16 * sl + c] = o[r]; } \
        _Pragma("unroll") for (int mt = 0; mt < 2; ++mt) { Sacc[mt] = Sacc[mt] * dl; \
            Sacc[mt] = __builtin_amdgcn_mfma_f32_16x16x32_bf16(*(const LAS bf16x8_t*)(im + GI_KT + (16 * (2 * wi + mt) + c) * 72 + 8 * g), v0, Sacc[mt], 0, 0, 0); \
            Sacc[mt] = __builtin_amdgcn_mfma_f32_16x16x32_bf16(*(const LAS bf16x8_t*)(im + GI_KT + (16 * (2 * wi + mt) + c) * 72 + 32 + 8 * g), v1, Sacc[mt], 0, 0, 0); \
            v2u w; w.x = pk2(Sacc[mt][0], Sacc[mt][1]); w.y = pk2(Sacc[mt][2], Sacc[mt][3]); *(LAS v2u*)(ST + (cur ^ 1) * 16 * STP + c * STP + 16 * (2 * wi + mt) + 4 * g) = w; } \
        gdn_stage_write(Y, IMG + (cur ^ 1) * GI_SZ, tid); \
        LDS_BAR(); } while (0)
    for (int n = 0; n < NCH; n += 2) { GDN_STEP2(A, B, n); GDN_STEP2(B, A, n + 1); }
#undef GDN_STEP2
}
constexpr int MI_Q = 0, MI_S = 4608, MI_K = 9216, MI_SZ = 13824;
struct MlStage { v4u r[3]; bf16x8_t vt[2]; float fl; };
__device__ __forceinline__ void ml_stage_load(MlStage& Sg, const Params& p, int item, int tid, int offV) {
    const bf16* MQ = (const bf16*)(p.ws + WS_MQ) + (size_t)item * 4096; const bf16* MS = (const bf16*)(p.ws + WS_MS) + (size_t)item * 4096; const bf16* MK = (const bf16*)(p.ws + WS_MK) + (size_t)item * 4096;
    const bf16* MV = (const bf16*)(p.ws + WS_MV) + (size_t)item * 9216;
    Sg.r[0] = *(const v4u*)(MQ + 8 * tid); Sg.r[1] = *(const v4u*)(MS + 8 * tid); Sg.r[2] = *(const v4u*)(MK + 8 * tid);
    Sg.vt[0] = *(const bf16x8_t*)(MV + offV); Sg.vt[1] = *(const bf16x8_t*)(MV + offV + 32);
    Sg.fl = ((const float*)(p.ws + WS_MFL))[item];
}
__device__ __forceinline__ void ml_stage_write(const MlStage& Sg, LAS unsigned short* img, int tid) {
    const int o = (tid >> 3) * 72 + 8 * (tid & 7);
    *(LAS v4u*)(img + MI_Q + o) = Sg.r[0]; *(LAS v4u*)(img + MI_S + o) = Sg.r[1]; *(LAS v4u*)(img + MI_K + o) = Sg.r[2];
}
__device__ __forceinline__ void ml_seq2(const Params& p, LAS unsigned char* lds, int wgi, int tid, int wave, int lane) {
    const int h = wgi / 5, sl0 = 2 * (wgi % 5) + (wave >> 2), wi = wave & 3, g = lane >> 4, c = lane & 15;
    const bool real = sl0 < 9; const int sl = real ? sl0 : 8;
    LAS unsigned short* IMG = (LAS unsigned short*)lds;
    LAS unsigned short* CT = (LAS unsigned short*)(lds + SEQ_UOFF + (wave >> 2) * 8192);
    float* HO = (float*)(p.ws + WS_HO); float* HDEN = (float*)(p.ws + WS_HDEN);
    const int offV = (16 * sl + c) * 64 + 8 * g;
    *(LAS v2u*)(CT + c * 72 + 16 * wi + 4 * g) = (v2u){0u, 0u};
    pg8::f32x4 Cacc = {0.f, 0.f, 0.f, 0.f};
    MlStage A, B;
    ml_stage_load(A, p, h, tid, offV); ml_stage_write(A, IMG, tid);
    ml_stage_load(B, p, 4 + h, tid, offV);
    LDS_BAR();
    constexpr int NCH = T / 64;
#define ML_STEP2(X, Y, n_) do { const int cur = (n_) & 1; const LAS unsigned short* im = IMG + cur * MI_SZ; const int ro = (16 * wi + c) * 72 + 8 * g; \
        const bf16x8_t c0 = *(const LAS bf16x8_t*)(CT + cur * 16 * 72 + c * 72 + 8 * g), c1 = *(const LAS bf16x8_t*)(CT + cur * 16 * 72 + c * 72 + 32 + 8 * g); \
        const bf16x8_t vt0 = X.vt[0], vt1 = X.vt[1]; const float fl = X.fl; \
        pg8::f32x4 num = {0.f, 0.f, 0.f, 0.f}; \
        num = __builtin_amdgcn_mfma_f32_16x16x32_bf16(*(const LAS bf16x8_t*)(im + MI_Q + ro), c0, num, 0, 0, 0); num = __builtin_amdgcn_mfma_f32_16x16x32_bf16(*(const LAS bf16x8_t*)(im + MI_Q + ro + 32), c1, num, 0, 0, 0); \
        num = __builtin_amdgcn_mfma_f32_16x16x32_bf16(*(const LAS bf16x8_t*)(im + MI_S + ro), vt0, num, 0, 0, 0); num = __builtin_amdgcn_mfma_f32_16x16x32_bf16(*(const LAS bf16x8_t*)(im + MI_S + ro + 32), vt1, num, 0, 0, 0); \
        Cacc = Cacc * fl; \
        Cacc = __builtin_amdgcn_mfma_f32_16x16x32_bf16(*(const LAS bf16x8_t*)(im + MI_K + ro), vt0, Cacc, 0, 0, 0); Cacc = __builtin_amdgcn_mfma_f32_16x16x32_bf16(*(const LAS bf16x8_t*)(im + MI_K + ro + 32), vt1, Cacc, 0, 0, 0); \
        ml_stage_load(X, p, (((n_) + 2 < NCH) ? (n_) + 2 : (n_)) * 4 + h, tid, offV); \
        { v2u w; w.x = pk2(Cacc[0], Cacc[1]); w.y = pk2(Cacc[2], Cacc[3]); *(LAS v2u*)(CT + (cur ^ 1) * 16 * 72 + c * 72 + 16 * wi + 4 * g) = w; } \
        { const size_t tb = (size_t)(n_) * 64 + 16 * wi + 4 * g; \
          if (sl < 8) { _Pragma("unroll") for (int r = 0; r < 4; ++r) HO[(tb + r) * BW + h * 128 + 16 * sl + c] = num[r]; } \
          else if (c == 0 && real) { _Pragma("unroll") for (int r = 0; r < 4; ++r) HDEN[(tb + r) * 4 + h] = num[r]; } } \
        ml_stage_write(Y, IMG + (cur ^ 1) * MI_SZ, tid); \
        LDS_BAR(); } while (0)
    for (int n = 0; n < NCH; n += 2) { ML_STEP2(A, B, n); ML_STEP2(B, A, n + 1); }
#undef ML_STEP2
}

__device__ __forceinline__ void mixer_gmlp_item(const Params& p, int l, LAS unsigned char* lds, int item, int tid, int wave, int lane) {
    const int chunk = item >> 2, g = item & 3; const size_t tok0 = (size_t)chunk * 128;
    const bf16* Z = (const bf16*)(p.ws + WS_Z); bf16* BR1 = (bf16*)(p.ws + WS_BR) + 1 * BW;
    const float* ng = p.in[I_GMNG] + l * BW; const float* nb = p.in[I_GMNB] + l * BW;
    const float* wsp = p.in[I_GMWS] + ((size_t)(l * 4 + g) * 128) * 128; const float* bsp = p.in[I_GMBS] + (l * 4 + g) * 128;
    LAS float* vn = (LAS float*)lds;
    for (int r = 0; r < 16; ++r) { const int tk = wave * 16 + r;
        const v4u raw = *(const v4u*)(Z + (tok0 + tk) * ZC + ZC_GMV + 8 * lane); float x[8]; unpack8(raw, x); float s = 0.f;
#pragma unroll
        for (int i = 0; i < 8; ++i) { x[i] = gelu_tanh(x[i]); s += x[i]; }
        const float mean = wave_sum(s) * (1.f / 512.f); float ss = 0.f;
#pragma unroll
        for (int i = 0; i < 8; ++i) { x[i] -= mean; ss += x[i] * x[i]; }
        const float rstd = rsqrtf(wave_sum(ss) * (1.f / 512.f) + LN_EPS);
        if ((lane >> 4) == g) { const int cl = 8 * (lane & 15);
#pragma unroll
            for (int i = 0; i < 8; ++i) vn[tk * 128 + cl + i] = x[i] * rstd * ng[8 * lane + i] + nb[8 * lane + i]; }
    }
    __syncthreads();
    const int t = tid >> 2, cq = tid & 3; float acc[32];
#pragma unroll
    for (int i = 0; i < 32; ++i) acc[i] = 0.f;
    const float* wrow = wsp + (size_t)t * 128;
    for (int s = 0; s <= t; ++s) { const float w = wrow[s]; const LAS float* row = vn + s * 128 + cq * 32;
#pragma unroll
        for (int i4 = 0; i4 < 8; ++i4) { const v4f a = *(const LAS v4f*)(row + 4 * i4); acc[4 * i4] += w * a.x; acc[4 * i4 + 1] += w * a.y; acc[4 * i4 + 2] += w * a.z; acc[4 * i4 + 3] += w * a.w; } }
    const float bias = bsp[t];
#pragma unroll
    for (int i8 = 0; i8 < 4; ++i8) { const v4u raw = *(const v4u*)(Z + (tok0 + t) * ZC + ZC_GMU + g * 128 + cq * 32 + 8 * i8); float u[8]; unpack8(raw, u); float o[8];
#pragma unroll
        for (int i = 0; i < 8; ++i) o[i] = gelu_tanh(u[i]) * (acc[8 * i8 + i] + bias);
#if MERGE_FP8
        *(v2u*)((unsigned char*)(p.ws + WS_BR) + (tok0 + t) * BRW + 1 * BW + g * 128 + cq * 32 + 8 * i8) = (v2u){pk4_f8(o[0], o[1], o[2], o[3], BRSC), pk4_f8(o[4], o[5], o[6], o[7], BRSC)}; }
#else
        v4u w; w.x = pk2(o[0], o[1]); w.y = pk2(o[2], o[3]); w.z = pk2(o[4], o[5]); w.w = pk2(o[6], o[7]);
        *(v4u*)(BR1 + (tok0 + t) * BRW + g * 128 + cq * 32 + 8 * i8) = w; }
#endif
    __syncthreads();
}

__device__ __forceinline__ void vt_item(const Params& p, LAS unsigned char* lds, int item, int tid) {
    const int h = item & 3, n = item >> 2; const size_t t0 = (size_t)n * 64;
    const bf16* Z = (const bf16*)(p.ws + WS_Z); bf16* VT = (bf16*)(p.ws + WS_VT);
    LAS unsigned short* vs = (LAS unsigned short*)lds;
#pragma unroll
    for (int r = 0; r < 2; ++r) { const int idx = tid + 512 * r, tk = idx >> 4, c8 = idx & 15;
        *(LAS v4u*)(vs + tk * 136 + 8 * c8) = *(const v4u*)(Z + (t0 + tk) * ZC + ZC_SBV + h * 128 + 8 * c8); }
    __syncthreads();
    { const int d = tid >> 2, jq = tid & 3; unsigned w[8];
#pragma unroll
      for (int x = 0; x < 8; ++x) w[x] = (unsigned)vs[(16 * jq + 2 * x) * 136 + d] | ((unsigned)vs[(16 * jq + 2 * x + 1) * 136 + d] << 16);
      bf16* dst = VT + ((size_t)h * 128 + d) * T + t0 + 16 * jq;
      *(v4u*)dst = (v4u){w[0], w[1], w[2], w[3]}; *(v4u*)(dst + 8) = (v4u){w[4], w[5], w[6], w[7]}; }
    __syncthreads();
}
constexpr int KTP = 136, VTP = 72;
__device__ __forceinline__ void sb_unit(const Params& p, LAS unsigned char* lds, int unit, int tid, int wave, int lane) {
    const int h = unit >> 6, q0 = (unit & 63) * 128, g = lane >> 4, c = lane & 15; const int qrow = q0 + 16 * wave + c;
    const bf16* Z = (const bf16*)(p.ws + WS_Z); const bf16* VT = (const bf16*)(p.ws + WS_VT) + (size_t)h * 128 * T; bf16* BR0 = (bf16*)(p.ws + WS_BR);
    LAS unsigned short* Kt = (LAS unsigned short*)lds;
    LAS unsigned short* Vt = Kt + 2 * 64 * KTP;
    LAS int* flags = (LAS int*)(Vt + 2 * 128 * VTP);
    bf16x8_t qf[4];
#pragma unroll
    for (int ks = 0; ks < 4; ++ks) qf[ks] = *(const bf16x8_t*)(Z + (size_t)qrow * ZC + ZC_SBQ + h * 128 + 32 * ks + 8 * g);
    pg8::f32x4 acc[8];
#pragma unroll
    for (int dt = 0; dt < 8; ++dt) acc[dt] = (pg8::f32x4){0.f, 0.f, 0.f, 0.f};
    float racc = 0.f;
    v4u kr[2], vr[2];
    const int jt = (q0 >> 6) + 1;
#define SB_GLOAD(j_) do { _Pragma("unroll") for (int r = 0; r < 2; ++r) { const int idx = tid + 512 * r; \
        kr[r] = *(const v4u*)(Z + (size_t)(64 * (j_) + (idx >> 4)) * ZC + ZC_SBK + h * 128 + 8 * (idx & 15)); \
        vr[r] = *(const v4u*)(VT + (size_t)(idx >> 3) * T + 64 * (j_) + 8 * (idx & 7)); } } while (0)
#define SB_LWRITE(b_) do { _Pragma("unroll") for (int r = 0; r < 2; ++r) { const int idx = tid + 512 * r; \
        *(LAS v4u*)(Kt + (b_) * 64 * KTP + (idx >> 4) * KTP + 8 * (idx & 15)) = kr[r]; *(LAS v4u*)(Vt + (b_) * 128 * VTP + (idx >> 3) * VTP + 8 * (idx & 7)) = vr[r]; } } while (0)
    LDS_BAR();
    SB_GLOAD(jt); SB_LWRITE(0);
    LDS_BAR();
    for (int j = jt, it = 0; j >= 0; --j, ++it) {
        const int cur = it & 1;
        SB_GLOAD(j > 0 ? j - 1 : 0);
        const bool wdone = __all(racc > 104.f);
        if (64 * j < q0 + 16 * wave + 15 && !wdone) {
            const LAS unsigned short* Kc = Kt + cur * 64 * KTP; const LAS unsigned short* Vc = Vt + cur * 128 * VTP;
            pg8::f32x4 z[4];
#pragma unroll
            for (int s = 0; s < 4; ++s) { z[s] = (pg8::f32x4){0.f, 0.f, 0.f, 0.f};
#pragma unroll
                for (int ks = 0; ks < 4; ++ks) z[s] = __builtin_amdgcn_mfma_f32_16x16x32_bf16(*(const LAS bf16x8_t*)(Kc + (16 * s + c) * KTP + 32 * ks + 8 * g), qf[ks], z[s], 0, 0, 0); }
            float sp[4][4], t[4], xs[4]; bool mk[4][4];
#pragma unroll
            for (int s = 0; s < 4; ++s) { t[s] = 0.f;
#pragma unroll
                for (int r = 0; r < 4; ++r) { const int key = 64 * j + 16 * s + 4 * g + r; mk[s][r] = key < qrow; const float zz = z[s][r] * 0.08838834764831845f; z[s][r] = zz;
                    sp[s][r] = mk[s][r] ? softplusf_(zz) : 0.f; t[s] += sp[s][r]; } }
            float grand = 0.f, higher[4];
#pragma unroll
            for (int s = 3; s >= 0; --s) { float x = t[s]; float y = __shfl(x, lane + 16); x += (g < 3) ? y : 0.f; y = __shfl(x, lane + 32); x += (g < 2) ? y : 0.f;
                xs[s] = x - t[s];
                const float tot = __shfl(x, c); higher[s] = grand; grand += tot; }
            bf16x8_t pf[2];
#pragma unroll
            for (int s = 0; s < 4; ++s) { float a[4]; float e = 0.f;
#pragma unroll
                for (int r = 3; r >= 0; --r) { const float la = z[s][r] - sp[s][r] - (racc + higher[s] + xs[s] + e); a[r] = mk[s][r] ? __expf(la) : 0.f; e += sp[s][r]; }
                const unsigned w0 = pk2(a[0], a[1]), w1 = pk2(a[2], a[3]);
                if ((s & 1) == 0) { pf[s >> 1][0] = (short)(w0 & 0xffff); pf[s >> 1][1] = (short)(w0 >> 16); pf[s >> 1][2] = (short)(w1 & 0xffff); pf[s >> 1][3] = (short)(w1 >> 16); }
                else              { pf[s >> 1][4] = (short)(w0 & 0xffff); pf[s >> 1][5] = (short)(w0 >> 16); pf[s >> 1][6] = (short)(w1 & 0xffff); pf[s >> 1][7] = (short)(w1 >> 16); } }
            racc += grand;
#pragma unroll
            for (int dt = 0; dt < 8; ++dt)
#pragma unroll
                for (int k2 = 0; k2 < 2; ++k2) { const v2u lo = *(const LAS v2u*)(Vc + (16 * dt + c) * VTP + 32 * k2 + 4 * g), hi = *(const LAS v2u*)(Vc + (16 * dt + c) * VTP + 32 * k2 + 16 + 4 * g);
                    const v4u vv = (v4u){lo.x, lo.y, hi.x, hi.y};
                    acc[dt] = __builtin_amdgcn_mfma_f32_16x16x32_bf16(__builtin_bit_cast(bf16x8_t, vv), pf[k2], acc[dt], 0, 0, 0); }
        }
        const bool wd2 = __all(racc > 104.f);
        if (lane == 0) flags[cur * 8 + wave] = wd2 ? 1 : 0;
        SB_LWRITE(cur ^ 1);
        LDS_BAR();
        int alld = 1;
#pragma unroll
        for (int w = 0; w < 8; ++w) alld &= flags[cur * 8 + w];
        if (alld) break;
    }
#undef SB_GLOAD
#undef SB_LWRITE
#pragma unroll
#if MERGE_FP8
    for (int dt = 0; dt < 8; ++dt) *(unsigned*)((unsigned char*)BR0 + (size_t)qrow * BRW + h * 128 + 16 * dt + 4 * g) = pk4_f8(acc[dt][0], acc[dt][1], acc[dt][2], acc[dt][3], BRSC);
#else
    for (int dt = 0; dt < 8; ++dt) { v2u w; w.x = pk2(acc[dt][0], acc[dt][1]); w.y = pk2(acc[dt][2], acc[dt][3]); *(v2u*)(BR0 + (size_t)qrow * BRW + h * 128 + 16 * dt + 4 * g) = w; }
#endif
}

struct GateOrder {
    pg8::StaticOrder s; int pn0;
    __device__ __forceinline__ bool next(int i, pg8::Unit& u) const { if (!s.next(i, u)) return false; u.pn += pn0; return true; }
    __device__ __forceinline__ void a_ready(const pg8::Unit&) const {}
    __device__ __forceinline__ void done(const pg8::Unit&) const {}
};
constexpr int GATE_PN0 = ZC_GATE / 256, GATE_WGS = 128;
__device__ __forceinline__ void phase_mixers(const Params& p, int l, LAS unsigned char* lds, int wg, int G, int tid, int wave, int lane, const XcdBarrier& bar) {
#if defined(PROBE_SPLIT)
    if (wg < 16) gdn_seq2(p, lds, wg, tid, wave, lane); else if (wg < 36) ml_seq2(p, lds, wg - 16, tid, wave, lane);
    xcd_barrier(bar);
    const int w2 = wg, G2 = G;
#else
    if (wg < 16) { gdn_seq2(p, lds, wg, tid, wave, lane); return; }
    if (wg < 36) { ml_seq2(p, lds, wg - 16, tid, wave, lane); return; }
    const int w2 = wg - 36, G2 = G - 36;
#endif
    if (GATE_SPLIT && G == 256) {
        if (w2 < GATE_WGS) {
            for (int it = w2; it < 256; it += GATE_WGS) mixer_gmlp_item(p, l, lds, it, tid, wave, lane);
            for (int it = w2; it < 256; it += GATE_WGS) sb_unit(p, lds, it, tid, wave, lane);
            __syncthreads();
            pg8::Gemm g{(const bf16*)(p.ws + WS_XB), (const bf16*)(p.ws + WS_WIN), T, ZC, D / 2, D / 2, D / 2}; GateOrder S; S.s.init(T, ZC - ZC_GATE, GATE_WGS, w2); S.pn0 = GATE_PN0;
            pg8::EpiBf16<0> E{(bf16*)(p.ws + WS_Z), ZC, nullptr, 0, 0, 1.f / 64.f};
            pg8::gemm_phase<pg8::EpiBf16<0>, GateOrder, true, true, true>(lds, g, S, E);
        } else { const int w3 = w2 - GATE_WGS, G3 = G2 - GATE_WGS; __syncthreads();
            phase_convert<1>(p, l, lds, w3 * 8 + wave, G3 * 8, wave, lane); }
        return; }
    for (int it = w2; it < 256; it += G2) mixer_gmlp_item(p, l, lds, it, tid, wave, lane);
    for (int it = w2; it < 256; it += G2) sb_unit(p, lds, it, tid, wave, lane);
#if !defined(PROBE_CONV0)
    __syncthreads();
    {
        constexpr int NIT1 = (NEX * 2 * (D / 64) * (ED / 32)) + (NEX * (ED / 64) * (D / 32));
        const int nheavy = (G2 < 256 && 2 * G2 >= 256) ? 256 - G2 : 0, per_wave = NIT1 / (G2 * 8);
        const int NA = (nheavy > 0 && per_wave > 2 * CONV_SKIP) ? (per_wave - CONV_SKIP) * (G2 * 8) : NIT1;
        phase_convert<1>(p, l, lds, w2 * 8 + wave, G2 * 8, wave, lane, false, 0, NA);
        if (NA < NIT1 && w2 >= nheavy) phase_convert<1>(p, l, lds, (w2 - nheavy) * 8 + wave, (G2 - nheavy) * 8, wave, lane, false, NA, NIT1); }
#endif
}

__device__ __forceinline__ void phase_post(const Params& p, int l, int gw, int NGW, int lane) {
    const bf16* Z = (const bf16*)(p.ws + WS_Z); const float* GO = (const float*)(p.ws + WS_GO); const float* HO = (const float*)(p.ws + WS_HO); const float* HDEN = (const float*)(p.ws + WS_HDEN);
    bf16* BR2 = (bf16*)(p.ws + WS_BR) + 2 * BW; bf16* BR3 = (bf16*)(p.ws + WS_BR) + 3 * BW;
    const float* gng = p.in[I_GDNNG] + l * 128; const float* mng = p.in[I_MLNG] + l * BW;
    for (int t = gw; t < T; t += NGW) {
        {   const v4f a0 = *(const v4f*)(GO + (size_t)t * BW + 8 * lane), a1 = *(const v4f*)(GO + (size_t)t * BW + 8 * lane + 4); float o[8] = {a0.x, a0.y, a0.z, a0.w, a1.x, a1.y, a1.z, a1.w}; float ss = 0.f;
#pragma unroll
            for (int i = 0; i < 8; ++i) ss += o[i] * o[i];
            const float r = rsqrtf(sum16(ss) * (1.f / 128.f) + LN_EPS);
            const v4u graw = *(const v4u*)(Z + (size_t)t * ZC + ZC_GDNG + 8 * lane); float gt[8]; unpack8(graw, gt);
#pragma unroll
            for (int i = 0; i < 8; ++i) o[i] = o[i] * r * gng[(8 * lane + i) & 127] * siluf_(gt[i]);
#if MERGE_FP8
            *(v2u*)((unsigned char*)(p.ws + WS_BR) + (size_t)t * BRW + 2 * BW + 8 * lane) = (v2u){pk4_f8(o[0], o[1], o[2], o[3], BRSC), pk4_f8(o[4], o[5], o[6], o[7], BRSC)}; }
#else
            v4u w; w.x = pk2(o[0], o[1]); w.y = pk2(o[2], o[3]); w.z = pk2(o[4], o[5]); w.w = pk2(o[6], o[7]); *(v4u*)(BR2 + (size_t)t * BRW + 8 * lane) = w; }
#endif
        {   const v4f a0 = *(const v4f*)(HO + (size_t)t * BW + 8 * lane), a1 = *(const v4f*)(HO + (size_t)t * BW + 8 * lane + 4); float o[8] = {a0.x, a0.y, a0.z, a0.w, a1.x, a1.y, a1.z, a1.w}; float ss = 0.f;
            const float dn = __builtin_amdgcn_rcpf(fmaxf(fabsf(HDEN[(size_t)t * 4 + (lane >> 4)]), 1.f));
#pragma unroll
            for (int i = 0; i < 8; ++i) { o[i] *= dn; ss += o[i] * o[i]; }
            const float r = rsqrtf(sum16(ss) * (1.f / 128.f) + LN_EPS);
            const v4u graw = *(const v4u*)(Z + (size_t)t * ZC + ZC_MLO + 8 * lane); float gt[8]; unpack8(graw, gt);
#pragma unroll
            for (int i = 0; i < 8; ++i) o[i] = o[i] * r * mng[8 * lane + i] * sigmoidf_(gt[i]);
#if MERGE_FP8
            *(v2u*)((unsigned char*)(p.ws + WS_BR) + (size_t)t * BRW + 3 * BW + 8 * lane) = (v2u){pk4_f8(o[0], o[1], o[2], o[3], BRSC), pk4_f8(o[4], o[5], o[6], o[7], BRSC)}; }
#else
            v4u w; w.x = pk2(o[0], o[1]); w.y = pk2(o[2], o[3]); w.z = pk2(o[4], o[5]); w.w = pk2(o[6], o[7]); *(v4u*)(BR3 + (size_t)t * BRW + 8 * lane) = w; }
#endif
    }
}

__device__ __forceinline__ void ln_row(const float* yrow, const float* g, const float* b, int lane, v4f (&v)[8]) {
    const v4f* yr = (const v4f*)yrow + lane; float s = 0.f;
#pragma unroll
    for (int j = 0; j < 8; ++j) { v[j] = yr[64 * j]; s += (v[j].x + v[j].y) + (v[j].z + v[j].w); }
    const float mean = wave_sum(s) * (1.f / D); float s2 = 0.f;
#pragma unroll
    for (int j = 0; j < 8; ++j) { v[j] = v[j] - mean; s2 += (v[j].x * v[j].x + v[j].y * v[j].y) + (v[j].z * v[j].z + v[j].w * v[j].w); }
    const float rstd = rsqrtf(wave_sum(s2) * (1.f / D) + LN_EPS);
#pragma unroll
    for (int j = 0; j < 8; ++j) { const v4f gg = ((const v4f*)g)[lane + 64 * j], bb = ((const v4f*)b)[lane + 64 * j]; v[j] = v[j] * rstd * gg + bb; }
}
constexpr int RT_XP = 2052;
constexpr int RT_TAB = 131072 + 1024;
__device__ __forceinline__ void phase_ln1_router(const Params& p, int l, LAS unsigned char* lds, int wg, int G, int wave, int lane, int cnt_shift = 0) {
    const bf16* Y = (const bf16*)(p.ws + WS_Y); bf16* X1 = (bf16*)(p.ws + WS_X1); bf16* X1B = (bf16*)(p.ws + WS_X1B); int* LIST = (int*)(p.ws + WS_LIST); float* WL = (float*)(p.ws + WS_WL); unsigned* SLOT = (unsigned*)(p.ws + WS_SLOT);
    unsigned* cnt = (unsigned*)(p.ws + WS_CTL) + CW_CNT + l * 4096 + cnt_shift;
    const float* g1 = p.in[I_LN1G] + (size_t)l * D; const float* b1 = p.in[I_LN1B] + (size_t)l * D;
    const float* wr = p.in[I_WR] + (size_t)l * D * NE; const float rbias = p.in[I_RB][l * NE + lane];
    LAS float* xt = (LAS float*)lds;
    LAS float* part = (LAS float*)lds;
    LAS unsigned char* selm = lds + RT_TAB; LAS unsigned char* rkm = selm + 4096; LAS float* wtm = (LAS float*)(rkm + 4096); LAS unsigned* basem = (LAS unsigned*)(wtm + 4096);
    const int n_l = lane & 15, kq = lane >> 4;
    int gi = 0;
    for (int tg = wg; tg < T / 16; tg += G, ++gi) {
        {   v4f va[8], vb[8]; const size_t m0 = (size_t)tg * 16 + 2 * wave;
#pragma unroll
            for (int j = 0; j < 8; ++j) { va[j] = ld4(Y, m0 * D + 4 * lane + 256 * j, true); vb[j] = ld4(Y, (m0 + 1) * D + 4 * lane + 256 * j, true); }
            float sa = 0.f, sb = 0.f;
#pragma unroll
            for (int j = 0; j < 8; ++j) { sa += (va[j].x + va[j].y) + (va[j].z + va[j].w); sb += (vb[j].x + vb[j].y) + (vb[j].z + vb[j].w); }
            const float ma = wave_sum(sa) * (1.f / D), mb = wave_sum(sb) * (1.f / D); float qa = 0.f, qb = 0.f;
#pragma unroll
            for (int j = 0; j < 8; ++j) { va[j] = va[j] - ma; vb[j] = vb[j] - mb; qa += (va[j].x * va[j].x + va[j].y * va[j].y) + (va[j].z * va[j].z + va[j].w * va[j].w); qb += (vb[j].x * vb[j].x + vb[j].y * vb[j].y) + (vb[j].z * vb[j].z + vb[j].w * vb[j].w); }
            const float ra = rsqrtf(wave_sum(qa) * (1.f / D) + LN_EPS), rb = rsqrtf(wave_sum(qb) * (1.f / D) + LN_EPS);
#pragma unroll
            for (int j = 0; j < 8; ++j) { const v4f gg = ((const v4f*)g1)[lane + 64 * j], bb = ((const v4f*)b1)[lane + 64 * j]; va[j] = va[j] * ra * gg + bb; vb[j] = vb[j] * rb * gg + bb; }
#pragma unroll
            for (int rr = 0; rr < 2; ++rr) { const size_t m = m0 + rr; v2u* xo = (v2u*)(X1 + m * D) + lane;
#pragma unroll
                for (int j = 0; j < 8; ++j) { const v4f v = rr ? vb[j] : va[j]; xo[64 * j] = (v2u){pk2(v.x, v.y), pk2(v.z, v.w)};
#if MOE_UP_FP8
                    { unsigned w = 0; w = __builtin_amdgcn_cvt_pk_fp8_f32(v.x, v.y, w, false); w = __builtin_amdgcn_cvt_pk_fp8_f32(v.z, v.w, w, true); ((unsigned*)((unsigned char*)X1B + m * D))[lane + 64 * j] = w; }
#else
                    { v2u o; o.x = pk2(v.x, v.y); o.y = pk2(v.z, v.w); ((v2u*)(X1B + m * D))[lane + 64 * j] = o; }
#endif
                    *(LAS v4f*)(xt + (2 * wave + rr) * RT_XP + 4 * lane + 256 * j) = v; } } }
        __syncthreads();
        {   pg8::f32x4 acc[4];
#pragma unroll
            for (int i = 0; i < 4; ++i) acc[i] = (pg8::f32x4){0.f, 0.f, 0.f, 0.f};
            const float* wb = wr + (size_t)(256 * wave + 4 * kq) * NE + 4 * n_l;
            const LAS float* xa = xt + n_l * RT_XP + 256 * wave + 4 * kq;
            v4f bwa[16], bwb[16];
#define RT_LOADW(dst, sb_) do { _Pragma("unroll") for (int q = 0; q < 16; ++q) dst[q] = *(const v4f*)(wb + (size_t)(16 * (4 * (sb_) + (q >> 2)) + (q & 3)) * NE); } while (0)
#define RT_MMA(src, sb_) do { _Pragma("unroll") for (int sg = 0; sg < 4; ++sg) { const v4f a4 = *(const LAS v4f*)(xa + 16 * (4 * (sb_) + sg)); \
                _Pragma("unroll") for (int c = 0; c < 4; ++c) { const v4f b4 = src[sg * 4 + c]; const float a = c == 0 ? a4.x : c == 1 ? a4.y : c == 2 ? a4.z : a4.w; \
                    acc[0] = __builtin_amdgcn_mfma_f32_16x16x4f32(a, b4.x, acc[0], 0, 0, 0); acc[1] = __builtin_amdgcn_mfma_f32_16x16x4f32(a, b4.y, acc[1], 0, 0, 0); \
                    acc[2] = __builtin_amdgcn_mfma_f32_16x16x4f32(a, b4.z, acc[2], 0, 0, 0); acc[3] = __builtin_amdgcn_mfma_f32_16x16x4f32(a, b4.w, acc[3], 0, 0, 0); } } } while (0)
            RT_LOADW(bwa, 0);
#pragma unroll 1
            for (int h = 0; h < 2; ++h) {
                RT_LOADW(bwb, 1); RT_MMA(bwa, 0);
                if (h == 0) RT_LOADW(bwa, 2);
                RT_MMA(bwb, 1);
                wb += (size_t)128 * NE; xa += 128; asm volatile("" : "+v"(wb));
            }
#undef RT_LOADW
#undef RT_MMA
            __syncthreads();
#pragma unroll
            for (int j = 0; j < 4; ++j) *(LAS v4f*)(part + (wave * 16 + 4 * kq + j) * 64 + 4 * n_l) = (v4f){acc[0][j], acc[1][j], acc[2][j], acc[3][j]}; }
        __syncthreads();
#pragma unroll 1
        for (int rr = 0; rr < 2; ++rr) { const int lr = wave + 8 * rr; float logit = 0.f;
#pragma unroll
            for (int w = 0; w < 8; ++w) logit += part[(w * 16 + lr) * 64 + lane];
            const float s = sigmoid_div(logit), biased = s + rbias;
            const float m1 = max8(biased); const float li = (float)(lane & 7);
            const float first = min8(biased == m1 ? li : 8.f);
            const float m2 = max8(li == first ? -INFINITY : biased);
            const float gs = m1 + m2; const int myg = lane >> 3; int grank = 0;
#pragma unroll
            for (int g2 = 0; g2 < 8; ++g2) { const float o = __builtin_bit_cast(float, __builtin_amdgcn_readlane(__builtin_bit_cast(int, gs), g2 * 8)); grank += (o > gs || (o == gs && g2 < myg)) ? 1 : 0; }
            const float masked = grank < 4 ? biased : -INFINITY; int rank = 0;
#pragma unroll 8
            for (int e2 = 0; e2 < 64; ++e2) { const float o = __builtin_bit_cast(float, __builtin_amdgcn_readlane(__builtin_bit_cast(int, masked), e2)); rank += (o > masked || (o == masked && e2 < lane)) ? 1 : 0; }
            const float wsel = rank < 6 ? s : 0.f; const float tot = wave_sum(wsel);
            const int ri = gi * 16 + lr;
            selm[ri * 64 + lane] = (rank < 6) ? 1 : 0; rkm[ri * 64 + lane] = (unsigned char)rank; wtm[ri * 64 + lane] = wsel / tot * 2.5f; }
        __syncthreads();
    }
    const int nrows = gi * 16;
    if (wave == 0) { unsigned n = 0;
        for (int r = 0; r < nrows; ++r) n += selm[r * 64 + lane];
        unsigned base = 0; if (n && !(PROBE_NOATOM && cnt_shift)) base = __hip_atomic_fetch_add(cnt + 64 * lane, n, __ATOMIC_RELAXED, __HIP_MEMORY_SCOPE_AGENT);
        basem[lane] = base; }
    __syncthreads();
    for (int ri = wave; ri < nrows; ri += 8) { unsigned pos = basem[lane];
        for (int r = 0; r < ri; ++r) pos += selm[r * 64 + lane];
        if (selm[ri * 64 + lane]) { const size_t m = (size_t)(wg + (ri >> 4) * G) * 16 + (ri & 15); const int rk = rkm[ri * 64 + lane];
            LIST[lane * T + pos] = (int)m; WL[lane * T + pos] = wtm[ri * 64 + lane]; SLOT[m * 8 + rk] = ((unsigned)lane << 16) | pos; } }
    __syncthreads();
}
__device__ __forceinline__ void phase_combine_ln2(const Params& p, int l, void* dst, bool dbf, int gw, int NGW, int lane) {
    const bf16* X1 = (const bf16*)(p.ws + WS_X1); const bf16* YE = (const bf16*)(p.ws + WS_YEXP); const unsigned* SLOT = (const unsigned*)(p.ws + WS_SLOT);
    const unsigned* cnt = (const unsigned*)(p.ws + WS_CTL) + CW_CNT + l * 4096;
    const float* g2 = p.in[I_LN2G] + (size_t)l * D; const float* b2 = p.in[I_LN2B] + (size_t)l * D;
    const int tiles = ((int)cnt[64 * lane] + 255) >> 8; const float incl = wave_scan_incl((float)tiles);
    const int toff = (int)incl - tiles;
    const int tsh = __builtin_amdgcn_readlane((int)incl, 63);
    for (int m = gw; m < T; m += NGW) {
        v4f v[8];
#pragma unroll
        for (int j = 0; j < 8; ++j) v[j] = ld4(X1, (size_t)m * D + 4 * lane + 256 * j, true) * ALPHA;
#pragma unroll
        for (int k = 0; k < 7; ++k) { size_t row;
            if (k == 0) row = (size_t)tsh * 256 + m;
            else { const unsigned s = __builtin_amdgcn_readfirstlane(SLOT[(size_t)m * 8 + (k - 1)]); const int e = (int)(s >> 16); row = (size_t)__builtin_amdgcn_readlane(toff, e) * 256 + (s & 0xffffu); }
#if YEXP_FP8
            const unsigned* yr = (const unsigned*)((const unsigned char*)YE + row * D) + lane;
#pragma unroll
            for (int j = 0; j < 8; ++j) { const unsigned y = yr[64 * j]; const auto lo = __builtin_amdgcn_cvt_pk_f32_fp8(y, false), hi = __builtin_amdgcn_cvt_pk_f32_fp8(y, true);
                v[j].x += lo[0] * (1.f / YSC); v[j].y += lo[1] * (1.f / YSC); v[j].z += hi[0] * (1.f / YSC); v[j].w += hi[1] * (1.f / YSC); } }
#else
            const v2u* yr = (const v2u*)(YE + row * D) + lane;
#pragma unroll
            for (int j = 0; j < 8; ++j) { const v2u y = yr[64 * j]; v[j].x += bflo(y.x); v[j].y += bfhi(y.x); v[j].z += bflo(y.y); v[j].w += bfhi(y.y); } }
#endif
        float s = 0.f;
#pragma unroll
        for (int j = 0; j < 8; ++j) s += (v[j].x + v[j].y) + (v[j].z + v[j].w);
        const float mean = wave_sum(s) * (1.f / D); float s2 = 0.f;
#pragma unroll
        for (int j = 0; j < 8; ++j) { v[j] = v[j] - mean; s2 += (v[j].x * v[j].x + v[j].y * v[j].y) + (v[j].z * v[j].z + v[j].w * v[j].w); }
        const float rstd = rsqrtf(wave_sum(s2) * (1.f / D) + LN_EPS);
#pragma unroll
        for (int j = 0; j < 8; ++j) { const v4f gg = ((const v4f*)g2)[lane + 64 * j], bb = ((const v4f*)b2)[lane + 64 * j]; const v4f o = v[j] * rstd * gg + bb;
            if (dbf) ((v2u*)((bf16*)dst + (size_t)m * D))[lane + 64 * j] = (v2u){pk2(o.x, o.y), pk2(o.z, o.w)};
            else ((v4f*)((float*)dst + (size_t)m * D))[lane + 64 * j] = o; }
    }
}

constexpr int NPH = 11;
template <class S> struct DupOrder {
    S s; int n;
    __device__ __forceinline__ bool next(int i, Unit& u) const { return s.next(i >= n ? i - n : i, u); }
    __device__ __forceinline__ int row_token(int i, int r) const { return s.row_token(i >= n ? i - n : i, r); }
    __device__ __forceinline__ void a_ready(const Unit& u) const { s.a_ready(u); }
    __device__ __forceinline__ void done(const Unit& u) const { s.done(u); }
};
template <class S> __device__ __forceinline__ int count_units(const S& s) { Unit u; int n = 0; while (n < 64 && s.next(n, u)) ++n; return n; }
#define ORDER_T(k, T) typename std::conditional<PROBE_DUP == (k), DupOrder<T>, T>::type
template <class S> __device__ __forceinline__ DupOrder<S> make_order(const S& s, std::true_type) { DupOrder<S> d{s, count_units(s)}; d.n = count_units(s); return d; }
template <class S> __device__ __forceinline__ S make_order(const S& s, std::false_type) { return s; }
#define MAKE_ORDER(k, s) make_order(s, std::integral_constant<bool, PROBE_DUP == (k)>())
template <int l>
__device__ __forceinline__ void run_layer(const Params& p, LAS unsigned char* lds, const XcdBarrier& bar, int tid, int lane, int wave, int G, int wg, int gw, int NGW) {
    unsigned char* ws = p.ws;
    {
        const void* xin = (l == 0) ? (const void*)p.in[I_X] : (const void*)(ws + WS_XCUR);
        void* xout = (l == NL - 1) ? (void*)p.out : (void*)(ws + WS_XCUR);
#ifndef PROBE_DUP
#define PROBE_DUP (-1)
#endif
#define IS_GEMM_PH(k) ((k) == 1 || (k) == 5 || (k) == 6 || (k) == 8 || (k) == 9)
#define REP(k) _Pragma("nounroll") for (int _r = 0; _r < ((PROBE_DUP == (k) && !IS_GEMM_PH(k)) ? 2 + (p.ph_lo >> 20) : 1); ++_r)
#ifndef PH_MASK
#define PH_MASK 0x7ff
#endif
#define RUN(k) (((PH_MASK >> (k)) & 1) && p.ph_lo <= l * NPH + (k) && l * NPH + (k) < p.ph_hi)
#define SEAM(k) do { if (l * NPH + (k) + 1 < p.ph_hi) xcd_barrier(bar); } while (0)
        if (RUN(0)) { REP(0) { phase_convert<0>(p, l, lds, gw, NGW, wave, lane);
#if defined(PROBE_CONV0)
            phase_convert<1>(p, l, lds, gw, NGW, wave, lane);
#endif
 phase_xprep(p, l, xin, l > 0, lds, gw, NGW, tid, lane); } SEAM(0); }
        if (RUN(1)) { REP(1) { pg8::Gemm g{(const bf16*)(ws + WS_XB), (const bf16*)(ws + WS_WIN), T, ZC, D / 2, D / 2, D / 2}; pg8::StaticOrder S; S.init(T, (GATE_SPLIT && G == 256) ? ZC_GATE : ZC, G, wg);
            pg8::EpiBf16<0> E{(bf16*)(ws + WS_Z), ZC, nullptr, 0, 0, 1.f / 64.f};
            auto S2 = MAKE_ORDER(1, S); pg8::gemm_phase<pg8::EpiBf16<0>, ORDER_T(1, pg8::StaticOrder), true, true, true>(lds, g, S2, E); } SEAM(1); }
        if (RUN(2)) { REP(2) { for (int it = wg; it < 1536; it += G) { if (it < 512) gdn_pre_item(p, l, lds, it, tid, wave, lane); else if (it < 1024) ml_pre_item(p, l, lds, it - 512, tid, wave, lane); else vt_item(p, lds, it - 1024, tid); } } SEAM(2); }
        if (RUN(3)) { REP(3) { phase_mixers(p, l, lds, wg, G, tid, wave, lane, bar); } SEAM(3); }
        if (RUN(4)) { REP(4) { phase_post(p, l, gw, NGW, lane); } SEAM(4); }
        if (RUN(5)) { REP(5) { constexpr int KM = MERGE_FP8 ? BRW / 2 : BRW; pg8::Gemm g{(const bf16*)(ws + WS_BR), (const bf16*)(ws + WS_WBR), T, D, KM, KM, KM}; pg8::StaticOrder S; S.init(T, D, G, wg);
            EpiMergeH E{(const bf16*)(ws + WS_Z), (bf16*)(ws + WS_MSUM)};
            auto S2 = MAKE_ORDER(5, S); pg8::gemm_phase<EpiMergeH, ORDER_T(5, pg8::StaticOrder), true, true, MERGE_FP8 != 0>(lds, g, S2, E); } SEAM(5); }
        if (RUN(6)) { REP(6) { pg8::Gemm g{(const bf16*)(ws + WS_MSUM), (const bf16*)(ws + WS_WOUT), T, D, D / 2, D / 2, D / 2}; pg8::StaticOrder S; S.init(T, D, G, wg);
            EpiResid E{xin, (bf16*)(ws + WS_Y), 1.f / 64.f, l > 0};
            auto S2 = MAKE_ORDER(6, S); pg8::gemm_phase<EpiResid, ORDER_T(6, pg8::StaticOrder), true, true, true>(lds, g, S2, E); } SEAM(6); }
        if (RUN(7)) { REP(7) { phase_ln1_router(p, l, lds, wg, G, wave, lane, (PROBE_DUP == 7 && _r == 0) ? 16384 : 0); } SEAM(7); }
        if (RUN(8)) { REP(8) { const unsigned* cnt = (const unsigned*)(ws + WS_CTL) + CW_CNT + l * 4096; MoeTab M(lds); moe_tables(M, cnt, tid, lane, wave);
            UpOrder S{M, 0}; S.n = up_order_build(M, (const int*)(ws + WS_LIST), (const float*)(ws + WS_WL), wg, G, tid);
            constexpr int KU = MOE_UP_FP8 ? D / 2 : D;
            pg8::Gemm g{(const bf16*)(ws + WS_X1B), (const bf16*)(ws + WS_WUP), T, NEX * 1024, KU, KU, KU};
            EpiGluSparse E{(LAS const float*)M.wt, (bf16*)(ws + WS_HB)};
            auto S2 = MAKE_ORDER(8, S); pg8::gemm_phase_gather<EpiGluSparse, ORDER_T(8, UpOrder), MOE_UP_FP8 != 0>(lds, g, S2, E); } SEAM(8); }
        if (RUN(9)) { REP(9) { const unsigned* cnt = (const unsigned*)(ws + WS_CTL) + CW_CNT + l * 4096; MoeTab M(lds); moe_tables(M, cnt, tid, lane, wave);
            DownOrder S{M, G, wg, 8 * M.t[65]};
            constexpr int KD = MOE_DN_FP8 ? ED / 2 : ED;
            pg8::Gemm g{(const bf16*)(ws + WS_HB), (const bf16*)(ws + WS_WDN), HROWS, NEX * D, KD, KD, KD};
            EpiYexp E{(bf16*)(ws + WS_YEXP)};
            auto S2 = MAKE_ORDER(9, S); pg8::gemm_phase<EpiYexp, ORDER_T(9, DownOrder), true, true, MOE_DN_FP8 != 0>(lds, g, S2, E); } SEAM(9); }
        if (RUN(10)) { REP(10) { phase_combine_ln2(p, l, xout, l != NL - 1, gw, NGW, lane); } SEAM(10); }
#undef RUN
#undef SEAM
    }
}
__global__ void __launch_bounds__(512, 2) fwd_kernel(Params p) {
    extern __shared__ __attribute__((aligned(16))) unsigned char lds_raw[];
    LAS unsigned char* lds = (LAS unsigned char*)lds_raw;
    const int tid = threadIdx.x, lane = tid & 63, wave = __builtin_amdgcn_readfirstlane(tid >> 6);
    const int G = gridDim.x, wg = blockIdx.x, gw = wg * 8 + wave, NGW = G * 8;
    volatile LAS unsigned* MISC = (volatile LAS unsigned*)(lds + MISC_OFF);
    if (tid < 32) MISC[tid] = 0u;
    __syncthreads();
    unsigned* ctl = (unsigned*)(p.ws + WS_CTL);
    const bool multi = (p.ph_hi - p.ph_lo) > 1;
    XcdBarrier bar; bar.bar = ctl + CW_BAR; bar.x = 0; bar.st = nullptr;
    if (multi) bar = xcd_barrier_post(ctl + CW_BAR, MISC + 8);
    run_layer<0>(p, lds, bar, tid, lane, wave, G, wg, gw, NGW);
    run_layer<1>(p, lds, bar, tid, lane, wave, G, wg, gw, NGW);
}

#ifndef MK_MULTI_LAUNCH
#define MK_MULTI_LAUNCH 0
#endif
extern "C" void kernel_launch(void* const* d_in, const int* in_sizes, int n_in, void* d_out, int out_size, void* d_ws, size_t ws_size, hipStream_t stream) {
    static int grid = 0;
    if (grid == 0) {
        if (n_in != 27 || out_size != T * D || ws_size < WS_END) { fprintf(stderr, "kernel_launch: unexpected shapes (n_in %d out %d ws %zu need %zu)\n", n_in, out_size, ws_size, (size_t)WS_END); grid = -1; return; }
        int dev = 0, cus = 0, per_cu = 0;
        if (hipGetDevice(&dev) != hipSuccess || hipDeviceGetAttribute(&cus, hipDeviceAttributeMultiprocessorCount, dev) != hipSuccess) { grid = -1; return; }
        if (hipFuncSetAttribute((const void*)fwd_kernel, hipFuncAttributeMaxDynamicSharedMemorySize, LDS_BYTES) != hipSuccess) { fprintf(stderr, "kernel_launch: hipFuncSetAttribute failed\n"); grid = -1; return; }
        if (hipOccupancyMaxActiveBlocksPerMultiprocessor(&per_cu, (const void*)fwd_kernel, 512, LDS_BYTES) != hipSuccess || per_cu < 1) { fprintf(stderr, "kernel_launch: occupancy query says %d\n", per_cu); }
        (void)hipGetLastError();
        grid = cus;
    }
    if (grid < 0) return;
    (void)hipMemsetAsync((char*)d_ws + WS_CTL, 0, CTL_ZERO_BYTES, stream);
    Params p{};
    for (int i = 0; i < 27; ++i) p.in[i] = (const float*)d_in[i];
    p.out = (float*)d_out; p.ws = (unsigned char*)d_ws;
#if MK_MULTI_LAUNCH
    for (int ph = 0; ph < NL * NPH; ++ph) { p.ph_lo = ph; p.ph_hi = ph + 1; hipLaunchKernelGGL(fwd_kernel, dim3(grid), dim3(512), LDS_BYTES, stream, p); }
#else
    p.ph_lo = 0; p.ph_hi = NL * NPH; hipLaunchKernelGGL(fwd_kernel, dim3(grid), dim3(512), LDS_BYTES, stream, p);
#endif
}
```

```cpp
#include <hip/hip_runtime.h>
#include <cstdio>
#include <cstdint>
#include <type_traits>
namespace pg8 {
#define PG8_LAS __attribute__((address_space(3)))
typedef unsigned short bf16_t;
typedef short bf16x8 __attribute__((ext_vector_type(8)));
typedef float f32x4 __attribute__((ext_vector_type(4)));
typedef unsigned u32x4 __attribute__((ext_vector_type(4)));
constexpr int BM = 256, BK = 64, HALF = 128, HTB = HALF * BK * 2  , STAGE_BYTES = 8 * HTB, NXCD = 8, WGM = 8;

__host__ __device__ __forceinline__ int lds_byte(int r, int c) { const int st = (r >> 4) * 2 + (c >> 5), rr = r & 15, cc = c & 31, ob = rr * 64 + cc * 2; return st * 1024 + (ob ^ (((ob >> 9) & 1) << 5)); }
__host__ __device__ __forceinline__ void stage_rc(int b, int& R, int& C) { const int st = b / 1024, sb = b % 1024, swz = sb ^ (((sb >> 9) & 1) << 5); R = (st >> 1) * 16 + swz / 64; C = (st & 1) * 32 + (swz % 64) / 2; }
__host__ __device__ __forceinline__ int perm32(int rho) { const int n = rho >> 4, i = rho & 15; return 8 * (i >> 2) + 4 * n + (i & 3); }

struct Unit { int pm, pn, aux; };
struct Gemm { const bf16_t* A; const bf16_t* Bt; int M, N, K, lda, ldb; };

struct StaticOrder {
    int nM, nN, nwg, G, c;
    __host__ __device__ void init(int M, int N, int G_, int c_) { nM = M / BM; nN = N / BM; nwg = nM * nN; G = G_; c = c_; }
    __host__ __device__ bool next(int i, Unit& u) const {
        const long L = (long)i * G + c; if (L >= nwg) return false;
        int wgid = (int)L; { const int q = nwg / NXCD, r = nwg % NXCD, xcd = wgid % NXCD, off = wgid / NXCD; wgid = (xcd < r ? xcd * (q + 1) : r * (q + 1) + (xcd - r) * q) + off; }
        const int nig = WGM * nN, gid = wgid / nig, fm = gid * WGM, gsz = (nM - fm) < WGM ? (nM - fm) : WGM;
        u.pm = fm + ((wgid % nig) % gsz); u.pn = (wgid % nig) / gsz; return true;
    }
    __device__ __forceinline__ void a_ready(const Unit&) const {}
    __device__ __forceinline__ void done(const Unit&) const {}
};

__device__ __forceinline__ unsigned cvt_pk_bf16(float lo, float hi) { unsigned r; asm volatile("v_cvt_pk_bf16_f32 %0, %1, %2" : "=v"(r) : "v"(lo), "v"(hi)); return r; }
typedef float f32x2 __attribute__((ext_vector_type(2)));
__device__ __forceinline__ f32x2 gelu_pk(f32x2 v) {
    const f32x2 av = __builtin_elementwise_abs(v), d = av * 0.2316418882f + 1.0f;
    f32x2 t; t.x = __builtin_amdgcn_rcpf(d.x); t.y = __builtin_amdgcn_rcpf(d.y);
    f32x2 q = t * 0.5307027145f + (-0.7265760135f); q = q * t + 0.7107068705f; q = q * t + (-0.142248368f); q = q * t + 0.127414796f; q = q * t;
    const f32x2 s = (v * v) * (-0.72134752044f);
    f32x2 e; e.x = __builtin_amdgcn_exp2f(s.x); e.y = __builtin_amdgcn_exp2f(s.y);
    const f32x2 m = v * (q * e), r = v - m;
    f32x2 o; o.x = v.x < 0.f ? m.x : r.x; o.y = v.y < 0.f ? m.y : r.y; return o;
}

template <int ACT  > struct EpiBf16 {
    static constexpr bool PERM = true, AFTER_DRAIN = false; static constexpr int MID = 0; static_assert(ACT == 0 || ACT == 1, "EpiBf16: ACT is 0 (none) or 1 (gelu_pk)");
    bf16_t* O; int ldc; const float* bias; int split_cols; size_t split_stride; float scale0;
    __device__ __forceinline__ void operator()(const f32x4 (&acc)[2][2][4][2], const Unit& u, int wr, int wc, int fr, int fq) const {
        const int row0 = u.pm * BM + wr * 64 + fr; int colt = u.pn * BM; bf16_t* base = O;
        float sc = scale0; if (split_cols) { const int t = colt / split_cols; base += (size_t)t * split_stride; colt -= t * split_cols; if (t != 0) sc = 1.f; }
        const int col0 = colt + wc * 32 + 8 * fq, bcol0 = u.pn * BM + wc * 32 + 8 * fq;
        f32x4 bv[2][2];
#pragma unroll
        for (int bj = 0; bj < 2; ++bj)
#pragma unroll
            for (int n = 0; n < 2; ++n) bv[bj][n] = bias ? *(const f32x4*)(bias + bcol0 + bj * HALF + 4 * n) : (f32x4){0.f, 0.f, 0.f, 0.f};
#pragma unroll
        for (int ai = 0; ai < 2; ++ai)
#pragma unroll
            for (int m = 0; m < 4; ++m) { bf16_t* rowp = base + (size_t)(row0 + ai * HALF + m * 16) * ldc + col0;
#pragma unroll
                for (int bj = 0; bj < 2; ++bj) { f32x4 v0 = acc[ai][bj][m][0] + bv[bj][0], v1 = acc[ai][bj][m][1] + bv[bj][1];
                    if (ACT == 1) { f32x2 a = gelu_pk((f32x2){v0[0], v0[1]}), b = gelu_pk((f32x2){v0[2], v0[3]}), c = gelu_pk((f32x2){v1[0], v1[1]}), d = gelu_pk((f32x2){v1[2], v1[3]});
                        v0 = (f32x4){a.x, a.y, b.x, b.y}; v1 = (f32x4){c.x, c.y, d.x, d.y}; }
                    v0 = v0 * sc; v1 = v1 * sc; u32x4 w; w.x = cvt_pk_bf16(v0[0], v0[1]); w.y = cvt_pk_bf16(v0[2], v0[3]); w.z = cvt_pk_bf16(v1[0], v1[1]); w.w = cvt_pk_bf16(v1[2], v1[3]);
                    *(u32x4*)(rowp + bj * HALF) = w; } }
    }
};

typedef int i32x8 __attribute__((ext_vector_type(8)));
__device__ __forceinline__ i32x8 cat8(const bf16x8 a, const bf16x8 b) { typedef int i32x4 __attribute__((ext_vector_type(4))); const i32x4 x = __builtin_bit_cast(i32x4, a), y = __builtin_bit_cast(i32x4, b); return (i32x8){x[0], x[1], x[2], x[3], y[0], y[1], y[2], y[3]}; }
__device__ __forceinline__ bf16x8 lo8(const i32x8 v) { typedef int i32x4 __attribute__((ext_vector_type(4))); return __builtin_bit_cast(bf16x8, __builtin_shufflevector(v, v, 0, 1, 2, 3)); }
__device__ __forceinline__ bf16x8 hi8(const i32x8 v) { typedef int i32x4 __attribute__((ext_vector_type(4))); return __builtin_bit_cast(bf16x8, __builtin_shufflevector(v, v, 4, 5, 6, 7)); }
template <class Epi, class Sched, bool ALIGN_EPI = false, bool SP2 = false, bool FP8 = false>
__device__ __forceinline__ void gemm_phase(PG8_LAS unsigned char* lds, const Gemm g, const Sched& S, const Epi& E) {
    const int tid = threadIdx.x, wid = __builtin_amdgcn_readfirstlane(tid >> 6), lane = tid & 63, wr = wid >> 2, wc = wid & 3, fr = lane & 15, fq = lane >> 4;
    const int K = g.K, nt = K / BK;
    unsigned voffA[2], voffB[2];
#pragma unroll
    for (int i = 0; i < 2; ++i) { int R, C; stage_rc(tid * 16 + i * 8192, R, C); const int Rb = Epi::PERM ? ((R & ~31) + perm32(R & 31)) : R;
        voffA[i] = (unsigned)(R * g.lda + C) * 2u; voffB[i] = (unsigned)(Rb * g.ldb + C) * 2u; }
    const size_t kstep = (size_t)(BK * 2);
    const size_t hstepA = (size_t)HALF * g.lda * 2, hstepB = (size_t)HALF * g.ldb * 2;
    const size_t tstepA = 2 * hstepA, tstepB = 2 * hstepB;
    const unsigned ldsw = (unsigned)wid * 1024u;
    const int aoff = lds_byte(wr * 64 + fr, fq * 8), boff = lds_byte(wc * 32 + fr, fq * 8);
#define PG8_SA(b, h) (((b) * 2 + (h)) * HTB)
#define PG8_SB(b, h) ((4 + (b) * 2 + (h)) * HTB)
#define PG8_STAGE(bufoff, gbase, voff) do { _Pragma("unroll") for (int _i = 0; _i < 2; ++_i) \
        __builtin_amdgcn_global_load_lds((const unsigned*)((const char*)(gbase) + (voff)[_i]), (PG8_LAS unsigned*)(lds + (bufoff) + ldsw + _i * 8192), 16, 0, 0); } while (0)
#define PG8_LDA(dst, b, h) do { _Pragma("unroll") for (int m = 0; m < 4; ++m) { if constexpr (FP8) dst##8[m] = cat8(*(const PG8_LAS bf16x8*)(lds + PG8_SA(b, h) + aoff + m * 2048), *(const PG8_LAS bf16x8*)(lds + PG8_SA(b, h) + aoff + m * 2048 + 1024)); \
        else { _Pragma("unroll") for (int k = 0; k < 2; ++k) dst[m][k] = *(const PG8_LAS bf16x8*)(lds + PG8_SA(b, h) + aoff + m * 2048 + k * 1024); } } } while (0)
#define PG8_LDB(dst, b, h) do { _Pragma("unroll") for (int n = 0; n < 2; ++n) { if constexpr (FP8) dst##8[n] = cat8(*(const PG8_LAS bf16x8*)(lds + PG8_SB(b, h) + boff + n * 2048), *(const PG8_LAS bf16x8*)(lds + PG8_SB(b, h) + boff + n * 2048 + 1024)); \
        else { _Pragma("unroll") for (int k = 0; k < 2; ++k) dst[n][k] = *(const PG8_LAS bf16x8*)(lds + PG8_SB(b, h) + boff + n * 2048 + k * 1024); } } } while (0)
#define PG8_MMA(ai, bj, At, Bt) do { __builtin_amdgcn_s_setprio(1); _Pragma("unroll") for (int m = 0; m < 4; ++m) _Pragma("unroll") for (int n = 0; n < 2; ++n) { \
        if constexpr (FP8) asm volatile("v_mfma_scale_f32_16x16x128_f8f6f4 %0, %1, %2, %0, %3, %3 op_sel_hi:[0,0,0]" : "+v"(acc[ai][bj][m][n]) : "v"(Bt##8[n]), "v"(At##8[m]), "v"(fp8_unit_scale)); \
        else { _Pragma("unroll") for (int k = 0; k < 2; ++k) acc[ai][bj][m][n] = __builtin_amdgcn_mfma_f32_16x16x32_bf16(Bt[n][k], At[m][k], acc[ai][bj][m][n], 0, 0, 0); } } __builtin_amdgcn_s_setprio(0); } while (0)
#define PG8_WAIT_V(n) asm volatile("s_waitcnt vmcnt(" #n ")" ::: "memory")
#define PG8_WAIT_L(n) asm volatile("s_waitcnt lgkmcnt(" #n ")" ::: "memory")
#define PG8_BAR __builtin_amdgcn_s_barrier()
#define PG8_SCHED __builtin_amdgcn_sched_barrier(0)
    Unit cur, nxt; int ui = 0;
    if (!S.next(0, cur)) return;
    f32x4 acc[2][2][4][2];
#pragma unroll
    for (int a = 0; a < 2; ++a)
#pragma unroll
        for (int b = 0; b < 2; ++b)
#pragma unroll
            for (int m = 0; m < 4; ++m)
#pragma unroll
                for (int n = 0; n < 2; ++n) acc[a][b][m][n] = (f32x4){0.f, 0.f, 0.f, 0.f};
    int fp8_unit_scale = 0x7F7F7F7F; asm volatile("" : "+v"(fp8_unit_scale));
    bf16x8 At[4][2], B0[2][2], B1[2][2];
    i32x8 At8[4], B08[2], B18[2];
    const char* cA = (const char*)g.A + (size_t)cur.pm * tstepA; const char* cB = (const char*)g.Bt + (size_t)cur.pn * tstepB;
    S.a_ready(cur);
    if constexpr (SP2) {
        PG8_STAGE(PG8_SB(0, 0), cB, voffB); PG8_STAGE(PG8_SB(0, 1), cB + hstepB, voffB); PG8_STAGE(PG8_SA(0, 0), cA, voffA); PG8_STAGE(PG8_SA(0, 1), cA + hstepA, voffA);
        if (wr == 1) PG8_BAR;
        PG8_WAIT_V(2); PG8_BAR;
        PG8_STAGE(PG8_SB(1, 0), cB + kstep, voffB); PG8_STAGE(PG8_SA(1, 0), cA + kstep, voffA); PG8_STAGE(PG8_SB(1, 1), cB + hstepB + kstep, voffB);
        PG8_WAIT_V(6); PG8_BAR;
    } else {
        PG8_STAGE(PG8_SB(0, 0), cB, voffB); PG8_STAGE(PG8_SA(0, 0), cA, voffA); PG8_STAGE(PG8_SB(0, 1), cB + hstepB, voffB); PG8_STAGE(PG8_SA(0, 1), cA + hstepA, voffA);
        if (wr == 1) PG8_BAR;
        PG8_WAIT_V(4); PG8_BAR;
        PG8_STAGE(PG8_SB(1, 0), cB + kstep, voffB); PG8_STAGE(PG8_SA(1, 0), cA + kstep, voffA); PG8_STAGE(PG8_SB(1, 1), cB + hstepB + kstep, voffB);
        PG8_WAIT_V(6); PG8_BAR;
    }
    for (;;) {
        const bool has_next = S.next(ui + 1, nxt);
        const char* nA = has_next ? (const char*)g.A + (size_t)nxt.pm * tstepA : cA; const char* nB = has_next ? (const char*)g.Bt + (size_t)nxt.pn * tstepB : cB;
        for (int t = 0; t < nt; t += 2) {
            const bool last = (t == nt - 2);
            const char* a1 = cA + (size_t)(t + 1) * kstep;
            const char* a2 = last ? nA : cA + (size_t)(t + 2) * kstep; const char* b2 = last ? nB : cB + (size_t)(t + 2) * kstep;
            const char* a3 = a2 + kstep; const char* b3 = b2 + kstep;
            if (last && has_next) S.a_ready(nxt);
            if constexpr (SP2) {
            if constexpr (Epi::MID > 0) { if (t != 0 && (t % Epi::MID) == 0) { PG8_SCHED; if constexpr (FP8) asm volatile("s_nop 7\n\ts_nop 7" ::: "memory"); E.mid(acc, cur, t / Epi::MID, wr, wc, fr, fq); if constexpr (FP8) asm volatile("s_nop 7" ::: "memory"); PG8_SCHED; } }
            PG8_LDB(B0, 0, 0); PG8_LDB(B1, 0, 1); PG8_SCHED; PG8_LDA(At, 0, 0); PG8_STAGE(PG8_SA(1, 1), a1 + hstepA, voffA);
            PG8_WAIT_V(8); PG8_WAIT_L(0); PG8_BAR; PG8_MMA(0, 0, At, B0); PG8_MMA(0, 1, At, B1); PG8_BAR; PG8_SCHED;
            PG8_LDA(At, 0, 1); PG8_STAGE(PG8_SB(0, 0), b2, voffB); PG8_STAGE(PG8_SB(0, 1), b2 + hstepB, voffB); PG8_STAGE(PG8_SA(0, 0), a2, voffA);
            PG8_WAIT_V(8); PG8_WAIT_L(0); PG8_BAR; PG8_MMA(1, 0, At, B0); PG8_MMA(1, 1, At, B1); PG8_BAR; PG8_SCHED;
            PG8_LDB(B0, 1, 0); PG8_LDB(B1, 1, 1); PG8_SCHED; PG8_LDA(At, 1, 0); PG8_STAGE(PG8_SA(0, 1), a2 + hstepA, voffA);
            PG8_WAIT_V(8); PG8_WAIT_L(0); PG8_BAR; PG8_MMA(0, 0, At, B0); PG8_MMA(0, 1, At, B1); PG8_BAR; PG8_SCHED;
            PG8_LDA(At, 1, 1); PG8_STAGE(PG8_SB(1, 0), b3, voffB); PG8_STAGE(PG8_SB(1, 1), b3 + hstepB, voffB); PG8_STAGE(PG8_SA(1, 0), a3, voffA);
            PG8_WAIT_V(8); PG8_WAIT_L(0); PG8_BAR; PG8_MMA(1, 0, At, B0); PG8_MMA(1, 1, At, B1); PG8_BAR; PG8_SCHED;
            } else {
            PG8_LDB(B0, 0, 0); PG8_SCHED; PG8_LDA(At, 0, 0); PG8_STAGE(PG8_SA(1, 1), a1 + hstepA, voffA);
            PG8_WAIT_L(8); PG8_BAR; PG8_WAIT_L(0); PG8_MMA(0, 0, At, B0); PG8_BAR; PG8_SCHED;
            PG8_LDB(B1, 0, 1); PG8_STAGE(PG8_SB(0, 0), b2, voffB);
            PG8_BAR; PG8_WAIT_L(0); PG8_MMA(0, 1, At, B1); PG8_BAR;
            PG8_LDA(At, 0, 1); PG8_STAGE(PG8_SA(0, 0), a2, voffA);
            PG8_BAR; PG8_WAIT_L(0); PG8_MMA(1, 0, At, B0); PG8_BAR; PG8_SCHED;
            PG8_STAGE(PG8_SB(0, 1), b2 + hstepB, voffB);
            PG8_WAIT_V(6); PG8_BAR; PG8_MMA(1, 1, At, B1); PG8_BAR;
            PG8_LDB(B0, 1, 0); PG8_SCHED; PG8_LDA(At, 1, 0); PG8_STAGE(PG8_SA(0, 1), a2 + hstepA, voffA);
            PG8_WAIT_L(8); PG8_BAR; PG8_WAIT_L(0); PG8_MMA(0, 0, At, B0); PG8_BAR; PG8_SCHED;
            PG8_LDB(B1, 1, 1); PG8_STAGE(PG8_SB(1, 0), b3, voffB);
            PG8_BAR; PG8_WAIT_L(0); PG8_MMA(0, 1, At, B1); PG8_BAR;
            PG8_LDA(At, 1, 1); PG8_STAGE(PG8_SA(1, 0), a3, voffA);
            PG8_BAR; PG8_WAIT_L(0); PG8_MMA(1, 0, At, B0); PG8_BAR; PG8_SCHED;
            PG8_STAGE(PG8_SB(1, 1), b3 + hstepB, voffB);
            PG8_WAIT_V(6); PG8_BAR; PG8_MMA(1, 1, At, B1); PG8_BAR;
            }
        }
        if constexpr (ALIGN_EPI) { if (wr == 0) PG8_BAR; }
        if constexpr (FP8) asm volatile("s_nop 7\n\ts_nop 7" ::: "memory");
        if constexpr (!Epi::AFTER_DRAIN) { E(acc, cur, wr, wc, fr, fq); S.done(cur); }
        if (!has_next) break;
#pragma unroll
        for (int a = 0; a < 2; ++a)
#pragma unroll
            for (int b = 0; b < 2; ++b)
#pragma unroll
                for (int m = 0; m < 4; ++m)
#pragma unroll
                    for (int n = 0; n < 2; ++n) acc[a][b][m][n] = (f32x4){0.f, 0.f, 0.f, 0.f};
        cur = nxt; cA = nA; cB = nB; ++ui;
        if constexpr (ALIGN_EPI) { if (wr == 1) PG8_BAR; }
    }
    PG8_WAIT_V(0);
    if constexpr (!ALIGN_EPI) { if (wr == 0) PG8_BAR; }
    PG8_BAR;
    if constexpr (Epi::AFTER_DRAIN) { E.fused(acc, cur, wr, wc, fr, fq, lds, wid, lane); S.done(cur); }
#undef PG8_SA
#undef PG8_SB
#undef PG8_STAGE
#undef PG8_LDA
#undef PG8_LDB
#undef PG8_MMA
#undef PG8_WAIT_V
#undef PG8_WAIT_L
#undef PG8_BAR
#undef PG8_SCHED
}
template <class Epi, class Sched, bool FP8 = false>
__device__ __forceinline__ void gemm_phase_gather(PG8_LAS unsigned char* lds, const Gemm g, const Sched& S, const Epi& E) {
    const int tid = threadIdx.x, wid = __builtin_amdgcn_readfirstlane(tid >> 6), lane = tid & 63, wr = wid >> 2, wc = wid & 3, fr = lane & 15, fq = lane >> 4;
    const int K = g.K, nt = K / BK;
    unsigned voffB[2]; int RA[2], CA[2];
#pragma unroll
    for (int i = 0; i < 2; ++i) { int R, C; stage_rc(tid * 16 + i * 8192, R, C); const int Rb = Epi::PERM ? ((R & ~31) + perm32(R & 31)) : R;
        RA[i] = R; CA[i] = C; voffB[i] = (unsigned)(Rb * g.ldb + C) * 2u; }
    const size_t kstep = (size_t)(BK * 2);
    const size_t hstepB = (size_t)HALF * g.ldb * 2, tstepB = 2 * hstepB;
    const unsigned ldsw = (unsigned)wid * 1024u;
    const int aoff = lds_byte(wr * 64 + fr, fq * 8), boff = lds_byte(wc * 32 + fr, fq * 8);
#define PG8_SA(b, h) (((b) * 2 + (h)) * HTB)
#define PG8_SB(b, h) ((4 + (b) * 2 + (h)) * HTB)
#define PG8_STAGE(bufoff, gbase, voff) do { _Pragma("unroll") for (int _i = 0; _i < 2; ++_i) \
        __builtin_amdgcn_global_load_lds((const unsigned*)((const char*)(gbase) + (voff)[_i]), (PG8_LAS unsigned*)(lds + (bufoff) + ldsw + _i * 8192), 16, 0, 0); } while (0)
#define PG8_LDA(dst, b, h) do { _Pragma("unroll") for (int m = 0; m < 4; ++m) { if constexpr (FP8) dst##8[m] = cat8(*(const PG8_LAS bf16x8*)(lds + PG8_SA(b, h) + aoff + m * 2048), *(const PG8_LAS bf16x8*)(lds + PG8_SA(b, h) + aoff + m * 2048 + 1024)); \
        else { _Pragma("unroll") for (int k = 0; k < 2; ++k) dst[m][k] = *(const PG8_LAS bf16x8*)(lds + PG8_SA(b, h) + aoff + m * 2048 + k * 1024); } } } while (0)
#define PG8_LDB(dst, b, h) do { _Pragma("unroll") for (int n = 0; n < 2; ++n) { if constexpr (FP8) dst##8[n] = cat8(*(const PG8_LAS bf16x8*)(lds + PG8_SB(b, h) + boff + n * 2048), *(const PG8_LAS bf16x8*)(lds + PG8_SB(b, h) + boff + n * 2048 + 1024)); \
        else { _Pragma("unroll") for (int k = 0; k < 2; ++k) dst[n][k] = *(const PG8_LAS bf16x8*)(lds + PG8_SB(b, h) + boff + n * 2048 + k * 1024); } } } while (0)
#define PG8_MMA(ai, bj, At, Bt) do { __builtin_amdgcn_s_setprio(1); _Pragma("unroll") for (int m = 0; m < 4; ++m) _Pragma("unroll") for (int n = 0; n < 2; ++n) { \
        if constexpr (FP8) asm volatile("v_mfma_scale_f32_16x16x128_f8f6f4 %0, %1, %2, %0, %3, %3 op_sel_hi:[0,0,0]" : "+v"(acc[ai][bj][m][n]) : "v"(Bt##8[n]), "v"(At##8[m]), "v"(fp8_unit_scale)); \
        else { _Pragma("unroll") for (int k = 0; k < 2; ++k) acc[ai][bj][m][n] = __builtin_amdgcn_mfma_f32_16x16x32_bf16(Bt[n][k], At[m][k], acc[ai][bj][m][n], 0, 0, 0); } } __builtin_amdgcn_s_setprio(0); } while (0)
#define PG8_WAIT_V(n) asm volatile("s_waitcnt vmcnt(" #n ")" ::: "memory")
#define PG8_WAIT_L(n) asm volatile("s_waitcnt lgkmcnt(" #n ")" ::: "memory")
#define PG8_BAR __builtin_amdgcn_s_barrier()
#define PG8_SCHED __builtin_amdgcn_sched_barrier(0)
#define PG8_ROWS(dst, ui_) do { _Pragma("unroll") for (int _h = 0; _h < 2; ++_h) _Pragma("unroll") for (int _i = 0; _i < 2; ++_i) \
        dst[_h][_i] = (unsigned)S.row_token((ui_), _h * HALF + RA[_i]) * (unsigned)(g.lda * 2) + (unsigned)(CA[_i] * 2); } while (0)
    Unit cur, nxt; int ui = 0;
    if (!S.next(0, cur)) return;
    f32x4 acc[2][2][4][2];
#pragma unroll
    for (int a = 0; a < 2; ++a)
#pragma unroll
        for (int b = 0; b < 2; ++b)
#pragma unroll
            for (int m = 0; m < 4; ++m)
#pragma unroll
                for (int n = 0; n < 2; ++n) acc[a][b][m][n] = (f32x4){0.f, 0.f, 0.f, 0.f};
    int fp8_unit_scale = 0x7F7F7F7F; asm volatile("" : "+v"(fp8_unit_scale));
    bf16x8 At[4][2], B0[2][2], B1[2][2];
    i32x8 At8[4], B08[2], B18[2];
    unsigned offC[2][2];
    PG8_ROWS(offC, 0);
    const char* gA = (const char*)g.A;
    const char* cB = (const char*)g.Bt + (size_t)cur.pn * tstepB;
    PG8_STAGE(PG8_SB(0, 0), cB, voffB); PG8_STAGE(PG8_SB(0, 1), cB + hstepB, voffB); PG8_STAGE(PG8_SA(0, 0), gA, offC[0]); PG8_STAGE(PG8_SA(0, 1), gA, offC[1]);
    if (wr == 1) PG8_BAR;
    PG8_WAIT_V(2); PG8_BAR;
    PG8_STAGE(PG8_SB(1, 0), cB + kstep, voffB); PG8_STAGE(PG8_SA(1, 0), gA + kstep, offC[0]); PG8_STAGE(PG8_SB(1, 1), cB + hstepB + kstep, voffB);
    PG8_WAIT_V(6); PG8_BAR;
    for (;;) {
        const bool has_next = S.next(ui + 1, nxt);
        const char* nB = has_next ? (const char*)g.Bt + (size_t)nxt.pn * tstepB : cB;
        for (int t = 0; t < nt; t += 2) {
            const bool last = (t == nt - 2);
            const char* a1 = gA + (size_t)(t + 1) * kstep;
            const char* a2 = last ? gA : gA + (size_t)(t + 2) * kstep; const char* b2 = last ? nB : cB + (size_t)(t + 2) * kstep;
            const char* a3 = a2 + kstep; const char* b3 = b2 + kstep;
            PG8_LDB(B0, 0, 0); PG8_LDB(B1, 0, 1); PG8_SCHED; PG8_LDA(At, 0, 0); PG8_STAGE(PG8_SA(1, 1), a1, offC[1]);
            if (last && has_next) { PG8_ROWS(offC, ui + 1); }
            PG8_WAIT_V(8); PG8_WAIT_L(0); PG8_BAR; PG8_MMA(0, 0, At, B0); PG8_MMA(0, 1, At, B1); PG8_BAR; PG8_SCHED;
            PG8_LDA(At, 0, 1); PG8_STAGE(PG8_SB(0, 0), b2, voffB); PG8_STAGE(PG8_SB(0, 1), b2 + hstepB, voffB); PG8_STAGE(PG8_SA(0, 0), a2, offC[0]);
            PG8_WAIT_V(8); PG8_WAIT_L(0); PG8_BAR; PG8_MMA(1, 0, At, B0); PG8_MMA(1, 1, At, B1); PG8_BAR; PG8_SCHED;
            PG8_LDB(B0, 1, 0); PG8_LDB(B1, 1, 1); PG8_SCHED; PG8_LDA(At, 1, 0); PG8_STAGE(PG8_SA(0, 1), a2, offC[1]);
            PG8_WAIT_V(8); PG8_WAIT_L(0); PG8_BAR; PG8_MMA(0, 0, At, B0); PG8_MMA(0, 1, At, B1); PG8_BAR; PG8_SCHED;
            PG8_LDA(At, 1, 1); PG8_STAGE(PG8_SB(1, 0), b3, voffB); PG8_STAGE(PG8_SB(1, 1), b3 + hstepB, voffB); PG8_STAGE(PG8_SA(1, 0), a3, offC[0]);
            PG8_WAIT_V(8); PG8_WAIT_L(0); PG8_BAR; PG8_MMA(1, 0, At, B0); PG8_MMA(1, 1, At, B1); PG8_BAR; PG8_SCHED;
        }
        if (wr == 0) PG8_BAR;
        if constexpr (FP8) asm volatile("s_nop 7\n\ts_nop 7" ::: "memory");
        E(acc, cur, wr, wc, fr, fq); S.done(cur);
        if (!has_next) break;
#pragma unroll
        for (int a = 0; a < 2; ++a)
#pragma unroll
            for (int b = 0; b < 2; ++b)
#pragma unroll
                for (int m = 0; m < 4; ++m)
#pragma unroll
                    for (int n = 0; n < 2; ++n) acc[a][b][m][n] = (f32x4){0.f, 0.f, 0.f, 0.f};
        cur = nxt; cB = nB; ++ui;
        if (wr == 1) PG8_BAR;
    }
    PG8_WAIT_V(0);
    PG8_BAR;
#undef PG8_ROWS
#undef PG8_SA
#undef PG8_SB
#undef PG8_STAGE
#undef PG8_LDA
#undef PG8_LDB
#undef PG8_MMA
#undef PG8_WAIT_V
#undef PG8_WAIT_L
#undef PG8_BAR
#undef PG8_SCHED
}
}

#ifndef GATE_SPLIT
#define GATE_SPLIT 1
#endif
#ifndef YEXP_FP8
#define YEXP_FP8 1
#endif
#ifndef CONV_SKIP
#define CONV_SKIP 6
#endif
#ifndef MERGE_FP8
#define MERGE_FP8 1
#endif
#ifndef MOE_DN_FP8
#define MOE_DN_FP8 1
#endif
#ifndef MOE_UP_FP8
#define MOE_UP_FP8 1
#endif
#ifndef PROBE_NOATOM
#define PROBE_NOATOM 0
#endif
constexpr int T = 8192, D = 2048, NL = 2, BW = 512, ZC = 14336, INC = 14352;
constexpr int NE = 64, NEX = 65  , ED = 512;
constexpr int BRW = 4 * BW;
constexpr int HK = NEX * ED;
constexpr float ALPHA = 1.41421356237f;
constexpr float LN_EPS = 1e-5f;
constexpr float UPSC = MOE_UP_FP8 ? (1.f / 64.f) : 1.f;
constexpr float BRSC = MERGE_FP8 ? 8.f : 1.f, MGSC = MERGE_FP8 ? (1.f / (8.f * 64.f)) : 1.f;
constexpr float YSC = 64.f;
constexpr float HSC = 8.f, DNSC = MOE_DN_FP8 ? (1.f / (HSC * 64.f)) : 1.f;
constexpr int ZC_SBQ = 0, ZC_SBK = 512, ZC_SBV = 1024, ZC_GMU = 1536, ZC_GMV = 2048, ZC_GDN = 2560, ZC_GDNG = 4096,
              ZC_MLQ = 4608, ZC_MLK = 4864, ZC_MLV = 5120, ZC_MLO = 5632, ZC_GATE = 6144;

#define GAS __attribute__((address_space(1)))
#define LAS __attribute__((address_space(3)))
typedef unsigned short bf16;
typedef unsigned v4u __attribute__((ext_vector_type(4)));
typedef unsigned v2u __attribute__((ext_vector_type(2)));
typedef float v4f __attribute__((ext_vector_type(4)));
typedef float v2f __attribute__((ext_vector_type(2)));
#define LDS_WAIT() asm volatile("s_waitcnt lgkmcnt(0)" ::: "memory")
#define LDS_BAR() do { asm volatile("s_waitcnt lgkmcnt(0)" ::: "memory"); __builtin_amdgcn_s_barrier(); asm volatile("" ::: "memory"); } while (0)

constexpr size_t MiB = 1u << 20;
constexpr size_t WS_CTL = 0, CTL_ZERO_BYTES = 1 * MiB;
constexpr size_t WS_WIN = 2 * MiB, WS_WBR = 58 * MiB, WS_WOUT = 66 * MiB, WS_WUP = 74 * MiB, WS_WDN = 334 * MiB;
constexpr size_t WS_XB = 464 * MiB, WS_SMALL = 496 * MiB, WS_EG = 497 * MiB, WS_BETA = WS_EG + 256 * 1024, WS_COMB = 498 * MiB;
constexpr size_t WS_Z = 500 * MiB, WS_GQ = 724 * MiB, WS_GK = 740 * MiB, WS_GV = 756 * MiB, WS_GO = 772 * MiB, WS_HO = 788 * MiB;
constexpr size_t WS_BR = 804 * MiB, WS_MTMP = 836 * MiB, WS_MSUM = 900 * MiB, WS_Y = 932 * MiB, WS_X1 = 996 * MiB, WS_X1B = 1060 * MiB;
constexpr size_t WS_XCUR = 1092 * MiB, WS_HB = 1156 * MiB, WS_YEXP = 1236 * MiB, WS_LIST = 1524 * MiB, WS_WL = 1526 * MiB, WS_SLOT = 1528 * MiB, WS_MQ = 1530 * MiB, WS_MS = 1534 * MiB, WS_MK = 1538 * MiB, WS_MV = 1542 * MiB, WS_MFL = 1552 * MiB, WS_HDEN = WS_MFL + 65536, WS_VT = 1553 * MiB, WS_END = 1561 * MiB;
constexpr size_t WS_GU = WS_GQ, WS_GNW = WS_GK, WS_GQG = WS_GK + 8 * MiB, WS_GKT = WS_GV, WS_GAT = WS_GV + 8 * MiB, WS_GDL = WS_GV + 12 * MiB;
constexpr int HROWS = 73728;
static_assert(WS_HB + (size_t)HROWS * ED * 2 <= WS_YEXP && WS_YEXP + (size_t)HROWS * D * 2 <= WS_LIST, "ws map (moe)");
static_assert(WS_WIN + (size_t)ZC * D * 2 <= WS_WBR && WS_WUP + (size_t)NEX * 1024 * D * 2 <= WS_WDN && WS_WDN + (size_t)D * HK * 2 <= WS_XB, "ws map (weights)");
static_assert(WS_Z + (size_t)T * ZC * 2 <= WS_GQ, "ws map (acts)");
constexpr int CW_BAR = 4096, CW_CNT = 16384;
constexpr int TAB_OFF = 131072 + 1024;
constexpr int LDS_BYTES = 163840, MISC_OFF = 131072 + 320;

__device__ __forceinline__ float bflo(unsigned w) { return __uint_as_float(w << 16); }
__device__ __forceinline__ float bfhi(unsigned w) { return __uint_as_float(w & 0xffff0000u); }
__device__ __forceinline__ unsigned f2bf(float f) { unsigned u = __float_as_uint(f); return (u + 0x7fffu + ((u >> 16) & 1u)) >> 16; }
typedef __bf16 bf16n2 __attribute__((ext_vector_type(2))); typedef float f32n2 __attribute__((ext_vector_type(2)));
__device__ __forceinline__ unsigned pk2(float lo, float hi) { const bf16n2 v = __builtin_convertvector((f32n2){lo, hi}, bf16n2); return __builtin_bit_cast(unsigned, v); }
__device__ __forceinline__ unsigned pk4_f8(float a, float b, float c, float d, float sc) {
    a = __builtin_amdgcn_fmed3f(a * sc, -448.f, 448.f); b = __builtin_amdgcn_fmed3f(b * sc, -448.f, 448.f); c = __builtin_amdgcn_fmed3f(c * sc, -448.f, 448.f); d = __builtin_amdgcn_fmed3f(d * sc, -448.f, 448.f);
    unsigned w = 0; w = __builtin_amdgcn_cvt_pk_fp8_f32(a, b, w, false); w = __builtin_amdgcn_cvt_pk_fp8_f32(c, d, w, true); return w; }
__device__ __forceinline__ v4f ld4(const void* base, size_t idx, bool is_bf16) {
    if (is_bf16) { const v2u r = *(const v2u*)((const unsigned short*)base + idx); return (v4f){bflo(r.x), bfhi(r.x), bflo(r.y), bfhi(r.y)}; }
    return *(const v4f*)((const float*)base + idx); }
template <int CTRL> __device__ __forceinline__ float dpp(float x) { return __builtin_bit_cast(float, __builtin_amdgcn_mov_dpp(__builtin_bit_cast(int, x), CTRL, 0xf, 0xf, true)); }
__device__ __forceinline__ float sum4(float x) { x += dpp<0xB1>(x); x += dpp<0x4E>(x); return x; }
__device__ __forceinline__ float sum8(float x) { x = sum4(x); x += dpp<0x141>(x); return x; }
__device__ __forceinline__ float sum16(float x) { x = sum8(x); x += dpp<0x140>(x); return x; }
__device__ __forceinline__ float wave_sum(float x) { x = sum16(x); x += __shfl_xor(x, 16); x += __shfl_xor(x, 32); return x; }
__device__ __forceinline__ float max8(float x) { x = fmaxf(x, dpp<0xB1>(x)); x = fmaxf(x, dpp<0x4E>(x)); x = fmaxf(x, dpp<0x141>(x)); return x; }
__device__ __forceinline__ float min8(float x) { x = fminf(x, dpp<0xB1>(x)); x = fminf(x, dpp<0x4E>(x)); x = fminf(x, dpp<0x141>(x)); return x; }
__device__ __forceinline__ float wave_scan_incl(float v) {
    v += __builtin_bit_cast(float, __builtin_amdgcn_update_dpp(0, __builtin_bit_cast(int, v), 0x111, 0xf, 0xf, true));
    v += __builtin_bit_cast(float, __builtin_amdgcn_update_dpp(0, __builtin_bit_cast(int, v), 0x112, 0xf, 0xf, true));
    v += __builtin_bit_cast(float, __builtin_amdgcn_update_dpp(0, __builtin_bit_cast(int, v), 0x114, 0xf, 0xf, true));
    v += __builtin_bit_cast(float, __builtin_amdgcn_update_dpp(0, __builtin_bit_cast(int, v), 0x118, 0xf, 0xf, true));
    v += __builtin_bit_cast(float, __builtin_amdgcn_update_dpp(0, __builtin_bit_cast(int, v), 0x142, 0xa, 0xf, false));
    v += __builtin_bit_cast(float, __builtin_amdgcn_update_dpp(0, __builtin_bit_cast(int, v), 0x143, 0xc, 0xf, false));
    return v;
}
__device__ __forceinline__ float sigmoidf_(float x) { return __builtin_amdgcn_rcpf(1.f + __expf(-x)); }
__device__ __forceinline__ float sigmoid_div(float x) { return 1.f / (1.f + __expf(-x)); }
__device__ __forceinline__ float siluf_(float x) { return x * __builtin_amdgcn_rcpf(1.f + __expf(-x)); }
__device__ __forceinline__ float softplusf_(float x) { return fmaxf(x, 0.f) + __logf(1.f + __expf(-fabsf(x))); }
__device__ __forceinline__ float gelu_tanh(float x) { const float y = 0.7978845608f * (x + 0.044715f * x * x * x); const float t = 1.f - 2.f * __builtin_amdgcn_rcpf(__expf(2.f * y) + 1.f); return 0.5f * x * (1.f + t); }
__device__ __forceinline__ void unpack8(const v4u r, float (&f)[8]) { f[0] = bflo(r.x); f[1] = bfhi(r.x); f[2] = bflo(r.y); f[3] = bfhi(r.y); f[4] = bflo(r.z); f[5] = bfhi(r.z); f[6] = bflo(r.w); f[7] = bfhi(r.w); }
#define XB_TMO      128
#define XB_XCNT(j)  (256  + 64 * (j))
#define XB_XSUB(j)  (1280 + 64 * (j))
#define XB_XGEN(j)  (2304 + 64 * (j))
#define XB_TOP      3328
#define XB_TOPGEN   3392
#define XCD_BAR_WORDS 3456
#define XB_SPIN_CAP (1u << 18)

__device__ __forceinline__ unsigned xb_ld(unsigned* p)              { return __hip_atomic_load(p, __ATOMIC_RELAXED, __HIP_MEMORY_SCOPE_AGENT); }
__device__ __forceinline__ unsigned xb_add(unsigned* p, unsigned v) { return __hip_atomic_fetch_add(p, v, __ATOMIC_RELAXED, __HIP_MEMORY_SCOPE_AGENT); }
__device__ __forceinline__ unsigned xb_xcc_id() { return (unsigned)__builtin_amdgcn_s_getreg((3 << 11) | 20) & 0xFu; }
#define XB_SPIN(cond, bar) do { unsigned _sp = 0; while (cond) { __builtin_amdgcn_s_sleep(1); \
    if ((++_sp & 255u) == 0u) { if (xb_ld(&(bar)[XB_TMO])) break; if (_sp > XB_SPIN_CAP) { atomicAdd(&(bar)[XB_TMO], 1u); break; } } } } while (0)

struct XcdBarrier {
    unsigned* bar; unsigned x;
    volatile LAS unsigned* st;
};

__device__ __forceinline__ XcdBarrier xcd_barrier_post(unsigned* bar, volatile LAS unsigned* st) {
    XcdBarrier b; b.bar = bar; b.x = xb_xcc_id(); b.st = st;
    if (threadIdx.x == 0) (void)xb_add(&bar[XB_XCNT(b.x)], 1u);
    return b;
}
__device__ __forceinline__ void xcd_barrier_complete(unsigned* bar, unsigned x, unsigned& nloc, unsigned& nx) {
    const unsigned G = gridDim.x * gridDim.y * gridDim.z;
    unsigned sum, cnt, mine, sp = 0u;
    for (;;) {
        sum = 0u; cnt = 0u; mine = 0u;
#pragma unroll
        for (unsigned j = 0; j < 16; ++j) { const unsigned c = xb_ld(&bar[XB_XCNT(j)]); sum += c; cnt += (c > 0u) ? 1u : 0u; mine = (j == x) ? c : mine; }
        if (sum == G) break;
        __builtin_amdgcn_s_sleep(1);
        if ((++sp & 255u) == 0u) { if (xb_ld(&bar[XB_TMO])) break; if (sp > XB_SPIN_CAP) { atomicAdd(&bar[XB_TMO], 1u); break; } }
    }
    nloc = mine > 0u ? mine : 1u; nx = cnt > 0u ? cnt : 1u;
}

__device__ __forceinline__ void xcd_barrier(const XcdBarrier& b) {
    asm volatile("s_waitcnt vmcnt(0)" ::: "memory");
    __syncthreads();
    if (threadIdx.x == 0) {
        unsigned* bar = b.bar;
        __builtin_amdgcn_s_waitcnt(0);
        unsigned nloc = b.st[0], nx = b.st[1];
        if (nloc == 0u) { xcd_barrier_complete(bar, b.x, nloc, nx); b.st[0] = nloc; b.st[1] = nx; }
        const unsigned old = xb_add(&bar[XB_XSUB(b.x)], 1u);
        const unsigned gen = old / nloc;
        if (old + 1u == (gen + 1u) * nloc) {
            __builtin_amdgcn_fence(__ATOMIC_RELEASE, "agent");
            asm volatile("s_waitcnt vmcnt(0)" ::: "memory");
            const unsigned og = xb_add(&bar[XB_TOP], 1u);
            const unsigned tg = og / nx;
            if (og + 1u == (tg + 1u) * nx) xb_add(&bar[XB_TOPGEN], 1u);
            else XB_SPIN(xb_ld(&bar[XB_TOPGEN]) == tg, bar);
            __builtin_amdgcn_fence(__ATOMIC_ACQUIRE, "agent");
            xb_add(&bar[XB_XGEN(b.x)], 1u);
            asm volatile("s_waitcnt vmcnt(0)" ::: "memory");
        } else {
            XB_SPIN(xb_ld(&bar[XB_XGEN(b.x)]) == gen, bar);
            __builtin_amdgcn_fence(__ATOMIC_ACQUIRE, "agent");
            asm volatile("s_waitcnt vmcnt(0)" ::: "memory");
        }
    }
    __syncthreads();
}

struct Params { const float* in[27]; float* out; unsigned char* ws; int ph_lo, ph_hi; };
enum { I_X = 0, I_WIN, I_GMNG, I_GMNB, I_GMWS, I_GMBS, I_CONVW, I_ALOG, I_DTB, I_GDNNG, I_MLIB, I_MLFB, I_MLNG, I_WBR, I_WOUT, I_LN1G, I_LN1B,
       I_WR, I_RB, I_WG, I_WU, I_WD, I_SG, I_SU, I_SD, I_LN2G, I_LN2B };

using pg8::f32x4; using pg8::u32x4; using pg8::Unit; using pg8::HALF; using pg8::BM;

struct EpiMergeH {
    static constexpr bool PERM = true, AFTER_DRAIN = false; static constexpr int MID = MERGE_FP8 ? BW / (2 * pg8::BK) : BW / pg8::BK;
    const bf16* Z; bf16* msum;
    __device__ __forceinline__ void mid(f32x4 (&acc)[2][2][4][2], const Unit& u, int j, int wr, int wc, int fr, int fq) const {
        int row0 = u.pm * BM + wr * 64 + fr; const int col0 = u.pn * BM + wc * 32 + 8 * fq; asm volatile("" : "+v"(row0));
        const bf16* zp = Z + ZC_GATE + (size_t)(j - 1) * D + col0;
        v4u ga[2][2][2], gb[2][2][2];
#define MH_LOAD(buf, am_) do { const int ai_ = (am_) >> 1, m0_ = ((am_) & 1) * 2; _Pragma("unroll") for (int m = 0; m < 2; ++m) _Pragma("unroll") for (int bj = 0; bj < 2; ++bj) { \
            const bf16* q = zp + (size_t)(row0 + ai_ * HALF + (m0_ + m) * 16) * ZC + bj * HALF; ga[buf][m][bj] = *(const v4u*)q; gb[buf][m][bj] = *(const v4u*)(q + D); } } while (0)
#define MH_APPLY(buf, am_) do { const int ai_ = (am_) >> 1, m0_ = ((am_) & 1) * 2; _Pragma("unroll") for (int m = 0; m < 2; ++m) _Pragma("unroll") for (int bj = 0; bj < 2; ++bj) { float a[8], b[8]; unpack8(ga[buf][m][bj], a); unpack8(gb[buf][m][bj], b); \
            _Pragma("unroll") for (int i = 0; i < 8; ++i) { const float ea = __builtin_amdgcn_exp2f(fmaxf(a[i], -60.f) * -1.44269504f), eb = __builtin_amdgcn_exp2f(fmaxf(b[i], -60.f) * -1.44269504f); \
                acc[ai_][bj][m0_ + m][i >> 2][i & 3] *= (1.f + eb) * __builtin_amdgcn_rcpf(1.f + ea); } } } while (0)
        MH_LOAD(0, 0); MH_LOAD(1, 1); asm volatile("" ::: "memory");
        MH_APPLY(0, 0); asm volatile("" ::: "memory"); MH_LOAD(0, 2); asm volatile("" ::: "memory");
        MH_APPLY(1, 1); asm volatile("" ::: "memory"); MH_LOAD(1, 3); asm volatile("" ::: "memory");
        MH_APPLY(0, 2); asm volatile("" ::: "memory");
        MH_APPLY(1, 3); asm volatile("" ::: "memory");
#undef MH_LOAD
#undef MH_APPLY
    }
    __device__ __forceinline__ void operator()(const f32x4 (&acc)[2][2][4][2], const Unit& u, int wr, int wc, int fr, int fq) const {
        const int row0 = u.pm * BM + wr * 64 + fr, col0 = u.pn * BM + wc * 32 + 8 * fq;
#pragma unroll
        for (int ai = 0; ai < 2; ++ai) { v4u gg[4][2];
#pragma unroll
            for (int m = 0; m < 4; ++m)
#pragma unroll
                for (int bj = 0; bj < 2; ++bj) gg[m][bj] = *(const v4u*)(Z + (size_t)(row0 + ai * HALF + m * 16) * ZC + ZC_GATE + 3 * D + col0 + bj * HALF);
#pragma unroll
            for (int m = 0; m < 4; ++m)
#pragma unroll
                for (int bj = 0; bj < 2; ++bj) { const size_t row = (size_t)(row0 + ai * HALF + m * 16); const int col = col0 + bj * HALF; float gl[8]; unpack8(gg[m][bj], gl);
                    f32x4 v0 = acc[ai][bj][m][0], v1 = acc[ai][bj][m][1];
#pragma unroll
                    for (int j = 0; j < 4; ++j) { v0[j] *= sigmoidf_(gl[j]) * MGSC; v1[j] *= sigmoidf_(gl[4 + j]) * MGSC; }
                    unsigned w0 = 0, w1 = 0; w0 = __builtin_amdgcn_cvt_pk_fp8_f32(v0[0], v0[1], w0, false); w0 = __builtin_amdgcn_cvt_pk_fp8_f32(v0[2], v0[3], w0, true); w1 = __builtin_amdgcn_cvt_pk_fp8_f32(v1[0], v1[1], w1, false); w1 = __builtin_amdgcn_cvt_pk_fp8_f32(v1[2], v1[3], w1, true);
                    *(v2u*)((unsigned char*)msum + row * D + col) = (v2u){w0, w1}; }
            asm volatile("" ::: "memory"); }
    }
};
struct EpiResid {
    static constexpr bool PERM = true, AFTER_DRAIN = false; static constexpr int MID = 0;
    const void* X; bf16* Y; float sc; bool xbf;
    __device__ __forceinline__ void operator()(const f32x4 (&acc)[2][2][4][2], const Unit& u, int wr, int wc, int fr, int fq) const {
        const int row0 = u.pm * BM + wr * 64 + fr, col0 = u.pn * BM + wc * 32 + 8 * fq;
#pragma unroll
        for (int ai = 0; ai < 2; ++ai)
#pragma unroll
            for (int m = 0; m < 4; ++m) { const size_t off = (size_t)(row0 + ai * HALF + m * 16) * D + col0;
#pragma unroll
                for (int bj = 0; bj < 2; ++bj) { const f32x4 x0 = ld4(X, off + bj * HALF, xbf), x1 = ld4(X, off + bj * HALF + 4, xbf);
                    const f32x4 v0 = x0 * ALPHA + acc[ai][bj][m][0] * sc, v1 = x1 * ALPHA + acc[ai][bj][m][1] * sc;
                    u32x4 w; w.x = pk2(v0[0], v0[1]); w.y = pk2(v0[2], v0[3]); w.z = pk2(v1[0], v1[1]); w.w = pk2(v1[2], v1[3]); *(u32x4*)(Y + off + bj * HALF) = w; } }
    }
};
struct MoeTab {
    LAS int* t; LAS unsigned short* tok; LAS float* wt; LAS unsigned char* mte;
    __device__ __forceinline__ MoeTab(LAS unsigned char* lds) : t((LAS int*)(lds + TAB_OFF)), tok((LAS unsigned short*)(lds + TAB_OFF + 1024)), wt((LAS float*)(lds + TAB_OFF + 5120)), mte((LAS unsigned char*)(lds + TAB_OFF + 13312)) {}
};
__device__ __forceinline__ void moe_tables(const MoeTab& M, const unsigned* cnt  , int tid, int lane, int wave) {
    __syncthreads();
    if (wave == 0) { const int c = (int)cnt[64 * lane]; const int tiles = (c + 255) >> 8; const float incl = wave_scan_incl((float)tiles);
        M.t[80 + lane] = c; M.t[lane] = (int)incl - tiles; if (lane == 63) { M.t[64] = (int)incl; M.t[65] = (int)incl + T / 256; M.t[80 + 64] = T; } }
    __syncthreads();
    const int Mt = M.t[65];
    for (int mt = tid; mt < Mt; mt += 512) { int e = 0;
        for (int k = 1; k <= 64; ++k) e = (M.t[k] <= mt) ? k : e;
        M.mte[mt] = (unsigned char)e; }
    __syncthreads();
}
struct UpOrder {
    MoeTab M; int n;
    __device__ __forceinline__ bool next(int i, Unit& u) const { if (i >= n) return false; u.pm = M.t[168 + i]; u.pn = M.t[176 + i]; u.aux = i; return true; }
    __device__ __forceinline__ int row_token(int i, int r) const { return (int)M.tok[i * 256 + r]; }
    __device__ __forceinline__ void a_ready(const Unit&) const {}
    __device__ __forceinline__ void done(const Unit&) const {}
};
__device__ __forceinline__ int up_order_build(const MoeTab& M, const int* LIST, const float* WL, int wg, int G, int tid) {
    const int U = 4 * M.t[65];
    if (tid < 8) { const int L = tid * G + wg; if (L < U) { const int mt = L >> 2, q = L & 3, e = M.mte[mt]; M.t[168 + tid] = mt; M.t[176 + tid] = e * 4 + q; M.t[184 + tid] = e; M.t[192 + tid] = mt - M.t[e]; } }
    int n = 0;
#pragma unroll
    for (int i = 0; i < 8; ++i) n += (i * G + wg < U) ? 1 : 0;
    __syncthreads();
    for (int idx = tid; idx < n * 256; idx += 512) { const int i = idx >> 8, r = idx & 255, e = M.t[184 + i], li = M.t[192 + i] * 256 + r;
        int tk = 0; float w = 0.f;
        if (e < NE) { if (li < M.t[80 + e]) { tk = LIST[e * T + li]; w = WL[e * T + li]; } } else { tk = li; w = 1.f; }
        M.tok[idx] = (unsigned short)tk; M.wt[idx] = w; }
    __syncthreads();
    return n;
}
struct EpiGluSparse {
    static constexpr bool PERM = true, AFTER_DRAIN = false; static constexpr int MID = 0;
    LAS const float* wt; bf16* H;
    __device__ __forceinline__ void operator()(const f32x4 (&acc)[2][2][4][2], const Unit& u, int wr, int wc, int fr, int fq) const {
        const int q = u.pn & 3; const int rl0 = wr * 64 + fr, col0 = q * 128 + wc * 32 + 8 * fq;
#pragma unroll
        for (int ai = 0; ai < 2; ++ai)
#pragma unroll
            for (int m = 0; m < 4; ++m) { const int rl = rl0 + ai * HALF + m * 16; const float c = wt[u.aux * 256 + rl]; float h[8];
#pragma unroll
                for (int n = 0; n < 2; ++n)
#pragma unroll
                    for (int j = 0; j < 4; ++j) h[4 * n + j] = siluf_(acc[ai][0][m][n][j] * UPSC) * (acc[ai][1][m][n][j] * UPSC) * c;
#if MOE_DN_FP8
#pragma unroll
                for (int j = 0; j < 8; ++j) h[j] = __builtin_amdgcn_fmed3f(h[j] * HSC, -448.f, 448.f);
                unsigned w0 = 0, w1 = 0; w0 = __builtin_amdgcn_cvt_pk_fp8_f32(h[0], h[1], w0, false); w0 = __builtin_amdgcn_cvt_pk_fp8_f32(h[2], h[3], w0, true); w1 = __builtin_amdgcn_cvt_pk_fp8_f32(h[4], h[5], w1, false); w1 = __builtin_amdgcn_cvt_pk_fp8_f32(h[6], h[7], w1, true);
                *(v2u*)((unsigned char*)H + ((size_t)u.pm * 256 + rl) * ED + col0) = (v2u){w0, w1}; }
#else
                u32x4 w; w.x = pk2(h[0], h[1]); w.y = pk2(h[2], h[3]); w.z = pk2(h[4], h[5]); w.w = pk2(h[6], h[7]);
                *(u32x4*)(H + ((size_t)u.pm * 256 + rl) * ED + col0) = w; }
#endif
    }
};
struct DownOrder {
    MoeTab M; int G, c, U;
    __device__ __forceinline__ bool next(int i, Unit& u) const { const int L = i * G + c; if (L >= U) return false; const int mt = L >> 3, e = (int)M.mte[mt]; u.pm = mt; u.pn = e * 8 + (L & 7); const int left = M.t[80 + e] - 256 * (mt - M.t[e]); u.aux = left < 256 ? left : 256; return true; }
    __device__ __forceinline__ void a_ready(const Unit&) const {}
    __device__ __forceinline__ void done(const Unit&) const {}
};
struct EpiYexp {
    static constexpr bool PERM = true, AFTER_DRAIN = false; static constexpr int MID = 0;
    bf16* Y;
    __device__ __forceinline__ void operator()(const f32x4 (&acc)[2][2][4][2], const Unit& u, int wr, int wc, int fr, int fq) const {
        const int row0 = u.pm * BM + wr * 64 + fr, col0 = (u.pn & 7) * BM + wc * 32 + 8 * fq;
#pragma unroll
        for (int ai = 0; ai < 2; ++ai)
#pragma unroll
            for (int m = 0; m < 4; ++m) { bf16* rowp = Y + (size_t)(row0 + ai * HALF + m * 16) * D + col0;
                if (wr * 64 + fr + ai * HALF + m * 16 >= u.aux) continue;
#pragma unroll
                for (int bj = 0; bj < 2; ++bj) { const f32x4 v0 = acc[ai][bj][m][0] * DNSC, v1 = acc[ai][bj][m][1] * DNSC;
#if YEXP_FP8
                    *(v2u*)((unsigned char*)Y + (size_t)(row0 + ai * HALF + m * 16) * D + col0 + bj * HALF) = (v2u){pk4_f8(v0[0], v0[1], v0[2], v0[3], YSC), pk4_f8(v1[0], v1[1], v1[2], v1[3], YSC)}; } }
#else
                    u32x4 w; w.x = pk2(v0[0], v0[1]); w.y = pk2(v0[2], v0[3]); w.z = pk2(v1[0], v1[1]); w.w = pk2(v1[2], v1[3]); *(u32x4*)(rowp + bj * HALF) = w; } }
#endif
    }
};

struct TrItem { const float* src; bf16* dst; unsigned sld, dld; int f8; };
__device__ __forceinline__ void tr_load(const TrItem& t, int lane, v4f (&v)[8]) { const int r8 = lane >> 3, c4 = lane & 7;
#pragma unroll
    for (int i = 0; i < 8; ++i) v[i] = *(const v4f*)(t.src + (size_t)(8 * i + r8) * t.sld + 4 * c4); }
__device__ __forceinline__ void tr_store(const TrItem& t, const v4f (&v)[8], LAS float* scr, int lane, bool nostore = false) {
    { const int r8 = lane >> 3, c4 = lane & 7;
#pragma unroll
      for (int i = 0; i < 8; ++i) { LAS float* d = scr + (8 * i + r8) * 33 + 4 * c4; d[0] = v[i].x; d[1] = v[i].y; d[2] = v[i].z; d[3] = v[i].w; } }
    LDS_WAIT(); asm volatile("" ::: "memory");
    if (nostore) return;
    if (t.f8) {
        const int c = lane & 3;
#pragma unroll
        for (int j = 0; j < 2; ++j) { const int n = (lane >> 2) + 16 * j; const LAS float* s = scr + (16 * c) * 33 + n; unsigned w[4];
#pragma unroll
            for (int q = 0; q < 4; ++q) { unsigned x = 0; x = __builtin_amdgcn_cvt_pk_fp8_f32(s[(4 * q) * 33] * 64.f, s[(4 * q + 1) * 33] * 64.f, x, false); x = __builtin_amdgcn_cvt_pk_fp8_f32(s[(4 * q + 2) * 33] * 64.f, s[(4 * q + 3) * 33] * 64.f, x, true); w[q] = x; }
            *(v4u*)((unsigned char*)t.dst + (size_t)n * t.dld + 16 * c) = (v4u){w[0], w[1], w[2], w[3]}; }
    } else {
        const int c = lane & 7;
#pragma unroll
        for (int j = 0; j < 4; ++j) { const int n = (lane >> 3) + 8 * j; const LAS float* s = scr + (8 * c) * 33 + n;
            v4u o; o.x = pk2(s[0 * 33], s[1 * 33]); o.y = pk2(s[2 * 33], s[3 * 33]); o.z = pk2(s[4 * 33], s[5 * 33]); o.w = pk2(s[6 * 33], s[7 * 33]);
            *(v4u*)(t.dst + (size_t)n * t.dld + 8 * c) = o; }
    }
    LDS_WAIT(); asm volatile("" ::: "memory");
}
template <int PART> __device__ __forceinline__ TrItem tr_decode(const Params& p, int l, int it) {
    unsigned char* ws = p.ws;
    constexpr int N_IN = (ZC / 32) * (D / 64), N_BR = 4 * (BW / 64) * (D / 32), N_OUT = (D / 64) * (D / 32), N_UP = NEX * 2 * (D / 64) * (ED / 32);
    int r = it; TrItem t; t.f8 = 0;
    if (PART == 0) {
        const float* w_in = p.in[I_WIN] + (size_t)l * D * INC; const float* w_br = p.in[I_WBR] + (size_t)l * 4 * BW * D; const float* w_out = p.in[I_WOUT] + (size_t)l * D * D;
        bf16* WIN = (bf16*)(ws + WS_WIN); bf16* WBR = (bf16*)(ws + WS_WBR); bf16* WOUT = (bf16*)(ws + WS_WOUT);
        if (r < N_IN) { const int kb = r / (ZC / 32), n0 = (r % (ZC / 32)) * 32, k0 = kb * 64; const int sc = n0 + (n0 >= ZC_GATE ? 16 : (n0 >= ZC_MLQ ? 8 : 0));
            t.src = w_in + (size_t)k0 * INC + sc; t.sld = INC; t.dst = (bf16*)((unsigned char*)WIN + (size_t)n0 * D + k0); t.dld = D; t.f8 = 1; return t; } r -= N_IN;
        if (r < N_BR) { const int g = r / 512, rr = r % 512, k0 = (rr / 64) * 64, n0 = (rr % 64) * 32;
            t.src = w_br + ((size_t)g * BW + k0) * D + n0; t.sld = D;
#if MERGE_FP8
            t.dst = (bf16*)((unsigned char*)WBR + (size_t)n0 * BRW + g * BW + k0); t.dld = BRW; t.f8 = 1; return t; }
#else
            t.dst = WBR + (size_t)n0 * BRW + g * BW + k0; t.dld = BRW; return t; }
#endif
        r -= N_BR;
        { const int k0 = (r / 64) * 64, n0 = (r % 64) * 32; t.src = w_out + (size_t)k0 * D + n0; t.sld = D; t.dst = (bf16*)((unsigned char*)WOUT + (size_t)n0 * D + k0); t.dld = D; t.f8 = 1; return t; }
    } else {
        const float* w_g = p.in[I_WG] + (size_t)l * NE * D * ED; const float* w_u = p.in[I_WU] + (size_t)l * NE * D * ED; const float* w_d = p.in[I_WD] + (size_t)l * NE * ED * D;
        const float* s_g = p.in[I_SG] + (size_t)l * D * ED; const float* s_u = p.in[I_SU] + (size_t)l * D * ED; const float* s_d = p.in[I_SD] + (size_t)l * ED * D;
        bf16* WUP = (bf16*)(ws + WS_WUP); bf16* WDN = (bf16*)(ws + WS_WDN);
        if (r < N_UP) { const int e = r / 1024, rr = r % 1024, mat = rr / 512, r2 = rr % 512, k0 = (r2 / 16) * 64, n0 = (r2 % 16) * 32;
            const float* sb = (e < NE) ? ((mat ? w_u : w_g) + (size_t)e * D * ED) : (mat ? s_u : s_g);
            const int drow = e * 1024 + (n0 / 128) * 256 + mat * 128 + (n0 % 128);
            t.src = sb + (size_t)k0 * ED + n0; t.sld = ED;
#if MOE_UP_FP8
            t.dst = (bf16*)((unsigned char*)WUP + (size_t)drow * D + k0); t.dld = D; t.f8 = 1; return t; }
#else
            t.dst = WUP + (size_t)drow * D + k0; t.dld = D; return t; }
#endif
        r -= N_UP;
        { const int e = r / 512, rr = r % 512, k0 = (rr / 64) * 64, n0 = (rr % 64) * 32;
            const float* sb = (e < NE) ? (w_d + (size_t)e * ED * D) : s_d;
            t.src = sb + (size_t)k0 * D + n0; t.sld = D;
#if MOE_DN_FP8
            t.dst = (bf16*)((unsigned char*)WDN + ((size_t)e * D + n0) * ED + k0); t.dld = ED; t.f8 = 1; return t; }
#else
            t.dst = WDN + ((size_t)e * D + n0) * ED + k0; t.dld = ED; return t; }
#endif
    }
}
template <int PART> __device__ __forceinline__ void phase_convert(const Params& p, int l, LAS unsigned char* lds, int gw, int NGW, int wave, int lane, bool nostore = false, int lo = 0, int hi = 1 << 30) {
    constexpr int N_IN = (ZC / 32) * (D / 64), N_BR = 4 * (BW / 64) * (D / 32), N_OUT = (D / 64) * (D / 32), N_UP = NEX * 2 * (D / 64) * (ED / 32), N_DN = NEX * (ED / 64) * (D / 32);
    constexpr int NITEMS = (PART == 0) ? (N_IN + N_BR + N_OUT) : (N_UP + N_DN);
    LAS float* scr = (LAS float*)(lds + wave * 16384);
    const int NIT = hi < NITEMS ? hi : NITEMS;
    if (lo + gw >= NIT) return;
    TrItem cur = tr_decode<PART>(p, l, lo + gw); v4f va[8], vb[8];
    tr_load(cur, lane, va);
    for (int it = lo + gw; it < NIT; it += 2 * NGW) {
        const int i1 = it + NGW, i2 = it + 2 * NGW; TrItem nx = cur;
        if (i1 < NIT) { nx = tr_decode<PART>(p, l, i1); } tr_load(nx, lane, vb);
        tr_store(cur, va, scr, lane, nostore);
        if (i1 >= NIT) break;
        cur = nx; if (i2 < NIT) { cur = tr_decode<PART>(p, l, i2); } tr_load(cur, lane, va);
        tr_store(nx, vb, scr, lane, nostore);
        if (i2 >= NIT) break;
    }
}
__device__ __forceinline__ void phase_xprep(const Params& p, int l, const void* xin, bool xbf, LAS unsigned char* lds, int gw, int NGW, int tid, int lane) {
    const float* w_in = p.in[I_WIN] + (size_t)l * D * INC;
    constexpr int XP = 2052; LAS float* xt = (LAS float*)lds; LAS float* part = (LAS float*)lds;
    const int wave = tid >> 6, n_l = lane & 15, kq = lane >> 4, wg = gw >> 3, G = NGW >> 3;
    const int colw = n_l < 8 ? 4608 + n_l : 6152 + (n_l - 8);
    float bw[64];
#pragma unroll
    for (int q = 0; q < 64; ++q) bw[q] = w_in[(size_t)(256 * wave + 16 * (q >> 2) + 4 * kq + (q & 3)) * INC + colw];
    unsigned char* XB = p.ws + WS_XB; float* SMALL = (float*)(p.ws + WS_SMALL);
    __syncthreads();
    for (int tg = wg; tg < T / 16; tg += G) {
        {   v4f va[8], vb[8]; const size_t m0 = (size_t)tg * 16 + 2 * wave;
#pragma unroll
            for (int j = 0; j < 8; ++j) { va[j] = ld4(xin, m0 * D + 4 * lane + 256 * j, xbf); vb[j] = ld4(xin, (m0 + 1) * D + 4 * lane + 256 * j, xbf); }
#pragma unroll
            for (int rr = 0; rr < 2; ++rr) { unsigned* xo = (unsigned*)(XB + (m0 + rr) * D) + lane;
#pragma unroll
                for (int j = 0; j < 8; ++j) { const v4f v = rr ? vb[j] : va[j]; unsigned w = 0; w = __builtin_amdgcn_cvt_pk_fp8_f32(v.x, v.y, w, false); w = __builtin_amdgcn_cvt_pk_fp8_f32(v.z, v.w, w, true); xo[64 * j] = w;
                    *(LAS v4f*)(xt + (2 * wave + rr) * XP + 4 * lane + 256 * j) = v; } } }
        __syncthreads();
        {   pg8::f32x4 acc[4];
#pragma unroll
            for (int i = 0; i < 4; ++i) acc[i] = (pg8::f32x4){0.f, 0.f, 0.f, 0.f};
            const LAS float* xa = xt + n_l * XP + 256 * wave + 4 * kq;
#pragma unroll
            for (int s2 = 0; s2 < 16; ++s2) { const v4f a4 = *(const LAS v4f*)(xa + 16 * s2);
                acc[0] = __builtin_amdgcn_mfma_f32_16x16x4f32(a4.x, bw[4 * s2 + 0], acc[0], 0, 0, 0); acc[1] = __builtin_amdgcn_mfma_f32_16x16x4f32(a4.y, bw[4 * s2 + 1], acc[1], 0, 0, 0);
                acc[2] = __builtin_amdgcn_mfma_f32_16x16x4f32(a4.z, bw[4 * s2 + 2], acc[2], 0, 0, 0); acc[3] = __builtin_amdgcn_mfma_f32_16x16x4f32(a4.w, bw[4 * s2 + 3], acc[3], 0, 0, 0); }
            const pg8::f32x4 tot = (acc[0] + acc[1]) + (acc[2] + acc[3]);
            __syncthreads();
#pragma unroll
            for (int j = 0; j < 4; ++j) part[(wave * 16 + 4 * kq + j) * 16 + n_l] = tot[j]; }
        __syncthreads();
        if (tid < 256) { float a = 0.f;
#pragma unroll
            for (int w = 0; w < 8; ++w) a += part[w * 256 + tid];
            SMALL[(size_t)tg * 256 + tid] = a; }
        __syncthreads();
    }
}


typedef short bf16x8_t __attribute__((ext_vector_type(8)));
__device__ __forceinline__ void ml_pre_item(const Params& p, int l, LAS unsigned char* lds, int item, int tid, int wave, int lane) {
    const int h = item & 3, n = item >> 2; const size_t t0 = (size_t)n * 64;
    const bf16* Z = (const bf16*)(p.ws + WS_Z); const float* SMALL = (const float*)(p.ws + WS_SMALL);
    bf16* MQ = (bf16*)(p.ws + WS_MQ) + (size_t)item * 4096; bf16* MS = (bf16*)(p.ws + WS_MS) + (size_t)item * 4096; bf16* MK = (bf16*)(p.ws + WS_MK) + (size_t)item * 4096;
    bf16* MV = (bf16*)(p.ws + WS_MV) + (size_t)item * 9216; float* MFL = (float*)(p.ws + WS_MFL);
    LAS float* qs = (LAS float*)lds;
    LAS float* ks = qs + 64 * 65;
    LAS float* bs = ks + 64 * 65;
    LAS unsigned short* vs = (LAS unsigned short*)(bs + 128);
    { const int tk = tid >> 3, c8 = tid & 7; float f[8];
      unpack8(*(const v4u*)(Z + (t0 + tk) * ZC + ZC_MLQ + h * 64 + 8 * c8), f);
#pragma unroll
      for (int i = 0; i < 8; ++i) qs[tk * 65 + 8 * c8 + i] = f[i];
      unpack8(*(const v4u*)(Z + (t0 + tk) * ZC + ZC_MLK + h * 64 + 8 * c8), f);
#pragma unroll
      for (int i = 0; i < 8; ++i) ks[tk * 65 + 8 * c8 + i] = f[i]; }
#pragma unroll
    for (int r = 0; r < 2; ++r) { const int idx = tid + 512 * r, tk = idx >> 4, c8 = idx & 15;
        *(LAS v4u*)(vs + tk * 136 + 8 * c8) = *(const v4u*)(Z + (t0 + tk) * ZC + ZC_MLV + h * 128 + 8 * c8); }
    if (wave == 0) { const float fp = SMALL[(t0 + lane) * 16 + 12 + h] + p.in[I_MLFB][l * 4 + h]; const float lf = -softplusf_(-fp);
        bs[lane] = wave_scan_incl(lf); bs[64 + lane] = SMALL[(t0 + lane) * 16 + 8 + h] + p.in[I_MLIB][l * 4 + h]; }
    __syncthreads();
    const float blast = bs[63];
    { const int i = tid >> 3, jb = tid & 7; const float bi = bs[i];
      { const float e = __expf(bi) * 0.125f; float o[8];
#pragma unroll
        for (int x = 0; x < 8; ++x) o[x] = qs[i * 65 + 8 * jb + x] * e;
        v4u w; w.x = pk2(o[0], o[1]); w.y = pk2(o[2], o[3]); w.z = pk2(o[4], o[5]); w.w = pk2(o[6], o[7]); *(v4u*)(MQ + i * 64 + 8 * jb) = w; }
      {
          const int ti = wave >> 1, c16 = lane & 15, g4 = lane >> 4, i2 = 16 * ti + c16; const float bi2 = bs[i2];
#define ML_F8(dst, base) do { const LAS float* _b = (base); const v4u _w = (v4u){pg8::cvt_pk_bf16(_b[0], _b[1]), pg8::cvt_pk_bf16(_b[2], _b[3]), pg8::cvt_pk_bf16(_b[4], _b[5]), pg8::cvt_pk_bf16(_b[6], _b[7])}; dst = __builtin_bit_cast(bf16x8_t, _w); } while (0)
          bf16x8_t bq[2];
#pragma unroll
          for (int s2 = 0; s2 < 2; ++s2) ML_F8(bq[s2], qs + i2 * 65 + 32 * s2 + 8 * g4);
#pragma unroll
          for (int jj = 0; jj < 2; ++jj) { const int tj = 2 * (wave & 1) + jj; v2u sw = (v2u){0u, 0u};
              if (tj <= ti) { pg8::f32x4 d = {0.f, 0.f, 0.f, 0.f};
#pragma unroll
                  for (int s2 = 0; s2 < 2; ++s2) { bf16x8_t a; ML_F8(a, ks + (16 * tj + c16) * 65 + 32 * s2 + 8 * g4); d = __builtin_amdgcn_mfma_f32_16x16x32_bf16(a, bq[s2], d, 0, 0, 0); }
                  float v4[4];
#pragma unroll
                  for (int r = 0; r < 4; ++r) { const int j = 16 * tj + 4 * g4 + r; v4[r] = (j <= i2) ? __expf(bi2 - bs[j] + bs[64 + j]) * d[r] * 0.125f : 0.f; }
                  sw = (v2u){pk2(v4[0], v4[1]), pk2(v4[2], v4[3])}; }
              *(v2u*)(MS + i2 * 64 + 16 * tj + 4 * g4) = sw; }
#undef ML_F8
      }
      { float o[8];
#pragma unroll
        for (int x = 0; x < 8; ++x) { const int j = 8 * jb + x; o[x] = ks[j * 65 + i] * __expf(blast - bs[j] + bs[64 + j]); }
        v4u w; w.x = pk2(o[0], o[1]); w.y = pk2(o[2], o[3]); w.z = pk2(o[4], o[5]); w.w = pk2(o[6], o[7]); *(v4u*)(MK + i * 64 + 8 * jb) = w; }
    }
    { const int c = tid >> 2, jq = tid & 3; unsigned w[8];
#pragma unroll
      for (int x = 0; x < 8; ++x) w[x] = (unsigned)vs[(16 * jq + 2 * x) * 136 + c] | ((unsigned)vs[(16 * jq + 2 * x + 1) * 136 + c] << 16);
      *(v4u*)(MV + c * 64 + 16 * jq) = (v4u){w[0], w[1], w[2], w[3]}; *(v4u*)(MV + c * 64 + 16 * jq + 8) = (v4u){w[4], w[5], w[6], w[7]};
      if (tid < 64) { const int c2 = 128 + (tid >> 2); const unsigned one = (c2 == 128) ? 0x3F803F80u : 0u;
          *(v4u*)(MV + c2 * 64 + 16 * jq) = (v4u){one, one, one, one}; *(v4u*)(MV + c2 * 64 + 16 * jq + 8) = (v4u){one, one, one, one}; } }
    if (tid == 0) MFL[item] = __expf(blast);
    __syncthreads();
}
struct MlFrags { bf16x8_t q[2], s[2], kt[2], vt[2]; float fl; };
__device__ __forceinline__ void ml_load(MlFrags& F, const Params& p, int item, int offA, int offV) {
    const bf16* MQ = (const bf16*)(p.ws + WS_MQ) + (size_t)item * 4096; const bf16* MS = (const bf16*)(p.ws + WS_MS) + (size_t)item * 4096; const bf16* MK = (const bf16*)(p.ws + WS_MK) + (size_t)item * 4096;
    const bf16* MV = (const bf16*)(p.ws + WS_MV) + (size_t)item * 9216;
#pragma unroll
    for (int ks = 0; ks < 2; ++ks) { F.q[ks] = *(const bf16x8_t*)(MQ + offA + 32 * ks); F.s[ks] = *(const bf16x8_t*)(MS + offA + 32 * ks); F.kt[ks] = *(const bf16x8_t*)(MK + offA + 32 * ks); F.vt[ks] = *(const bf16x8_t*)(MV + offV + 32 * ks); }
    F.fl = ((const float*)(p.ws + WS_MFL))[item];
}
__device__ __forceinline__ void ml_seq(const Params& p, LAS unsigned char* lds, int wgi, int wave, int lane) {
    const int u = wgi * 2 + (wave >> 2), wi = wave & 3, h = u / 9, sl = u % 9, g = lane >> 4, c = lane & 15;
    LAS unsigned short* CT = (LAS unsigned short*)(lds + (wave >> 2) * 4096);
    float* HO = (float*)(p.ws + WS_HO); float* HDEN = (float*)(p.ws + WS_HDEN);
    const int offA = (16 * wi + c) * 64 + 8 * g, offV = (16 * sl + c) * 64 + 8 * g;
    *(LAS v2u*)(CT + c * 64 + 16 * wi + 4 * g) = (v2u){0u, 0u};
    pg8::f32x4 Cacc = {0.f, 0.f, 0.f, 0.f};
    __syncthreads();
    MlFrags F0, F1;
    ml_load(F0, p, h, offA, offV);
#define ML_STEP(F, n_) do { const int cur = (n_) & 1; \
        const bf16x8_t c0 = *(const LAS bf16x8_t*)(CT + cur * 1024 + c * 64 + 8 * g), c1 = *(const LAS bf16x8_t*)(CT + cur * 1024 + c * 64 + 32 + 8 * g); \
        pg8::f32x4 num = {0.f, 0.f, 0.f, 0.f}; \
        num = __builtin_amdgcn_mfma_f32_16x16x32_bf16(F.q[0], c0, num, 0, 0, 0); num = __builtin_amdgcn_mfma_f32_16x16x32_bf16(F.q[1], c1, num, 0, 0, 0); \
        num = __builtin_amdgcn_mfma_f32_16x16x32_bf16(F.s[0], F.vt[0], num, 0, 0, 0); num = __builtin_amdgcn_mfma_f32_16x16x32_bf16(F.s[1], F.vt[1], num, 0, 0, 0); \
        Cacc = Cacc * F.fl; \
        Cacc = __builtin_amdgcn_mfma_f32_16x16x32_bf16(F.kt[0], F.vt[0], Cacc, 0, 0, 0); Cacc = __builtin_amdgcn_mfma_f32_16x16x32_bf16(F.kt[1], F.vt[1], Cacc, 0, 0, 0); \
        { v2u w; w.x = pk2(Cacc[0], Cacc[1]); w.y = pk2(Cacc[2], Cacc[3]); *(LAS v2u*)(CT + (cur ^ 1) * 1024 + c * 64 + 16 * wi + 4 * g) = w; } \
        { const size_t tb = (size_t)(n_) * 64 + 16 * wi + 4 * g; \
          if (sl < 8) { _Pragma("unroll") for (int r = 0; r < 4; ++r) HO[(tb + r) * BW + h * 128 + 16 * sl + c] = num[r]; } \
          else if (c == 0) { _Pragma("unroll") for (int r = 0; r < 4; ++r) HDEN[(tb + r) * 4 + h] = num[r]; } } \
        LDS_BAR(); } while (0)
    for (int n = 0; n < T / 64; n += 2) {
        ml_load(F1, p, (n + 1) * 4 + h, offA, offV);
        ML_STEP(F0, n);
        ml_load(F0, p, ((n + 2 < T / 64) ? n + 2 : n) * 4 + h, offA, offV);
        ML_STEP(F1, n + 1);
    }
#undef ML_STEP
}


constexpr int QP = 132;
__device__ __forceinline__ void gdn_pre_item(const Params& p, int l, LAS unsigned char* lds, int item, int tid, int wave, int lane) {
    const int h = item & 3, n = item >> 2; const size_t t0 = (size_t)n * 64;
    const bf16* Z = (const bf16*)(p.ws + WS_Z); const float* SMALL = (const float*)(p.ws + WS_SMALL);
    float* GU = (float*)(p.ws + WS_GU) + (size_t)item * 8192; bf16* GNW = (bf16*)(p.ws + WS_GNW) + (size_t)item * 8192; bf16* GQG = (bf16*)(p.ws + WS_GQG) + (size_t)item * 8192;
    bf16* GAT = (bf16*)(p.ws + WS_GAT) + (size_t)item * 4096; bf16* GKT = (bf16*)(p.ws + WS_GKT) + (size_t)item * 8192; float* GDL = (float*)(p.ws + WS_GDL);
    const float* cw = p.in[I_CONVW] + (size_t)l * 4 * 1536;
    LAS float* qs = (LAS float*)lds; LAS float* ks = qs + 64 * QP; LAS float* vs = ks + 64 * QP; LAS float* Ls = vs + 64 * QP;   LAS float* gcs = Ls + 64 * 68; LAS float* bts = gcs + 64; LAS float* btg = bts + 64;
    LAS unsigned short* zq = (LAS unsigned short*)(lds + 131584); LAS unsigned short* zk = (LAS unsigned short*)Ls; LAS unsigned short* zv = (LAS unsigned short*)vs; LAS float* cwl = btg + 64;
    float gate_b = 0.f, gate_a = 0.f; if (wave == 0) { gate_b = SMALL[(t0 + lane) * 16 + h]; gate_a = SMALL[(t0 + lane) * 16 + 4 + h]; }
    {   v4u zr[7]; v4f wr4 = (v4f){0.f, 0.f, 0.f, 0.f};
#pragma unroll
        for (int q = 0; q < 7; ++q) { const int idx = tid + 512 * q; zr[q] = (v4u){0u, 0u, 0u, 0u};
            if (idx < 3216) { const int seg = idx / 1072, rem = idx % 1072, r = rem >> 4, c16 = rem & 15; const long tt = (long)t0 - 3 + r;
                if (tt >= 0) zr[q] = *(const v4u*)(Z + (size_t)tt * ZC + ZC_GDN + seg * 512 + h * 128 + 8 * c16); } }
        if (tid < 384) { const int j = tid / 96, rest = tid % 96, i = rest >> 5, c4 = rest & 31; wr4 = *(const v4f*)(cw + j * 1536 + i * 512 + h * 128 + 4 * c4); }
#pragma unroll
        for (int q = 0; q < 7; ++q) { const int idx = tid + 512 * q;
            if (idx < 3216) { const int seg = idx / 1072, rem = idx % 1072; LAS unsigned short* zb = seg == 0 ? zq : (seg == 1 ? zk : zv); *(LAS v4u*)(zb + 8 * rem) = zr[q]; } }
        if (tid < 384) *(LAS v4f*)(cwl + 4 * tid) = wr4;
    }
    __syncthreads();
    { const int tk = tid >> 3, part = tid & 7; float av[16];
#pragma unroll 1
      for (int i = 0; i < 3; ++i) { float a[16]; const LAS unsigned short* zb = i == 0 ? zq : (i == 1 ? zk : zv);
#pragma unroll
        for (int x = 0; x < 16; ++x) a[x] = 0.f;
#pragma unroll
        for (int j = 0; j < 4; ++j) { const LAS unsigned short* src = zb + (tk + j) * 128 + 16 * part; float x0[8], x1[8]; unpack8(*(const LAS v4u*)src, x0); unpack8(*(const LAS v4u*)(src + 8), x1);
            const LAS float* wp = cwl + (j * 3 + i) * 128 + 16 * part;
#pragma unroll
            for (int x4 = 0; x4 < 2; ++x4) { const v4f w0 = *(const LAS v4f*)(wp + 4 * x4), w1 = *(const LAS v4f*)(wp + 8 + 4 * x4);
                a[4 * x4] += w0.x * x0[4 * x4]; a[4 * x4 + 1] += w0.y * x0[4 * x4 + 1]; a[4 * x4 + 2] += w0.z * x0[4 * x4 + 2]; a[4 * x4 + 3] += w0.w * x0[4 * x4 + 3];
                a[8 + 4 * x4] += w1.x * x1[4 * x4]; a[8 + 4 * x4 + 1] += w1.y * x1[4 * x4 + 1]; a[8 + 4 * x4 + 2] += w1.z * x1[4 * x4 + 2]; a[8 + 4 * x4 + 3] += w1.w * x1[4 * x4 + 3]; } }
        float ss = 0.f;
#pragma unroll
        for (int x = 0; x < 16; ++x) { a[x] = siluf_(a[x]); ss += a[x] * a[x]; }
        if (i < 2) { ss = sum8(ss); const float r = rsqrtf(ss + 1e-6f) * (i == 0 ? 0.08838834764831845f : 1.f);
#pragma unroll
            for (int x = 0; x < 16; ++x) a[x] *= r;
            LAS float* dst = (i == 0 ? qs : ks) + tk * QP + 16 * part;
#pragma unroll
            for (int x4 = 0; x4 < 4; ++x4) *(LAS v4f*)(dst + 4 * x4) = (v4f){a[4 * x4], a[4 * x4 + 1], a[4 * x4 + 2], a[4 * x4 + 3]}; }
        else {
#pragma unroll
            for (int x = 0; x < 16; ++x) av[x] = a[x]; } }
      __syncthreads();
      { LAS float* dst = vs + tk * QP + 16 * part;
#pragma unroll
        for (int x4 = 0; x4 < 4; ++x4) *(LAS v4f*)(dst + 4 * x4) = (v4f){av[4 * x4], av[4 * x4 + 1], av[4 * x4 + 2], av[4 * x4 + 3]}; } }
    if (wave == 0) { const float bb = gate_b, aa = gate_a;
        const float g = -__expf(p.in[I_ALOG][l * 4 + h]) * softplusf_(aa + p.in[I_DTB][l * 4 + h]);
        const float gc = wave_scan_incl(g), bt = sigmoidf_(bb); gcs[lane] = gc; bts[lane] = bt; btg[lane] = bt * __expf(gc); }
    __syncthreads();
    { const int ti = wave >> 1, c16 = lane & 15, g4 = lane >> 4, i = 16 * ti + c16; const float gi = gcs[i], bi = bts[i];
#define GDN_F8(dst, base) do { const v4f _a = *(const LAS v4f*)(base), _b = *(const LAS v4f*)((base) + 4); const v4u _w = (v4u){pg8::cvt_pk_bf16(_a.x, _a.y), pg8::cvt_pk_bf16(_a.z, _a.w), pg8::cvt_pk_bf16(_b.x, _b.y), pg8::cvt_pk_bf16(_b.z, _b.w)}; dst = __builtin_bit_cast(bf16x8_t, _w); } while (0)
      bf16x8_t bk[4], bq[4];
#pragma unroll
      for (int s4 = 0; s4 < 4; ++s4) { GDN_F8(bk[s4], ks + i * QP + 32 * s4 + 8 * g4); GDN_F8(bq[s4], qs + i * QP + 32 * s4 + 8 * g4); }
#pragma unroll
      for (int jj = 0; jj < 2; ++jj) { const int tj = 2 * (wave & 1) + jj; v4f lv = (v4f){0.f, 0.f, 0.f, 0.f}; v2u aw = (v2u){0u, 0u};
          if (tj <= ti) { pg8::f32x4 dk = {0.f, 0.f, 0.f, 0.f}, dq = {0.f, 0.f, 0.f, 0.f};
#pragma unroll
              for (int s4 = 0; s4 < 4; ++s4) { bf16x8_t a; GDN_F8(a, ks + (16 * tj + c16) * QP + 32 * s4 + 8 * g4);
                  dk = __builtin_amdgcn_mfma_f32_16x16x32_bf16(a, bk[s4], dk, 0, 0, 0); dq = __builtin_amdgcn_mfma_f32_16x16x32_bf16(a, bq[s4], dq, 0, 0, 0); }
              float l4[4], a4[4];
#pragma unroll
              for (int r = 0; r < 4; ++r) { const int j = 16 * tj + 4 * g4 + r; const float dc = __expf(gi - gcs[j]); l4[r] = (j < i) ? bi * dk[r] * dc : 0.f; a4[r] = (j <= i) ? dq[r] * dc : 0.f; }
              lv = (v4f){l4[0], l4[1], l4[2], l4[3]}; aw = (v2u){pk2(a4[0], a4[1]), pk2(a4[2], a4[3])}; }
          *(LAS v4f*)(Ls + i * 68 + 16 * tj + 4 * g4) = lv; *(v2u*)(GAT + i * 64 + 16 * tj + 4 * g4) = aw; }
#undef GDN_F8
    }
    __syncthreads();
    if (tid < 256) {
        const int c = tid; int vz; asm volatile("v_mov_b32 %0, 0" : "=v"(vz));
        const LAS float* rp = (c < 128) ? (vs + c) : (ks + (c - 128)); const LAS float* mp = ((c < 128) ? bts : btg) + vz;
#define GDN_RHS(i) (rp[(i) * QP] * mp[(i)])
#define GDN_L4(i, j4) (*(const LAS v4f*)(Ls + (i) * 68 + 4 * (j4) + vz))
        float x0 = GDN_RHS(0); __builtin_amdgcn_sched_barrier(0);
        float x1 = GDN_RHS(1); { const v4f l0 = GDN_L4(1, 0); __builtin_amdgcn_sched_barrier(0); x1 -= l0.x * x0; } __builtin_amdgcn_sched_barrier(0);
        float x2 = GDN_RHS(2); { const v4f l0 = GDN_L4(2, 0); __builtin_amdgcn_sched_barrier(0); x2 -= l0.x * x0; x2 -= l0.y * x1; } __builtin_amdgcn_sched_barrier(0);
        float x3 = GDN_RHS(3); { const v4f l0 = GDN_L4(3, 0); __builtin_amdgcn_sched_barrier(0); x3 -= l0.x * x0; x3 -= l0.y * x1; x3 -= l0.z * x2; } __builtin_amdgcn_sched_barrier(0);
        float x4 = GDN_RHS(4); { const v4f l0 = GDN_L4(4, 0); __builtin_amdgcn_sched_barrier(0); x4 -= l0.x * x0; x4 -= l0.y * x1; x4 -= l0.z * x2; x4 -= l0.w * x3; } __builtin_amdgcn_sched_barrier(0);
        float x5 = GDN_RHS(5); { const v4f l0 = GDN_L4(5, 0); const v4f l1 = GDN_L4(5, 1); __builtin_amdgcn_sched_barrier(0); x5 -= l0.x * x0; x5 -= l0.y * x1; x5 -= l0.z * x2; x5 -= l0.w * x3; x5 -= l1.x * x4; } __builtin_amdgcn_sched_barrier(0);
        float x6 = GDN_RHS(6); { const v4f l0 = GDN_L4(6, 0); const v4f l1 = GDN_L4(6, 1); __builtin_amdgcn_sched_barrier(0); x6 -= l0.x * x0; x6 -= l0.y * x1; x6 -= l0.z * x2; x6 -= l0.w * x3; x6 -= l1.x * x4; x6 -= l1.y * x5; } __builtin_amdgcn_sched_barrier(0);
        float x7 = GDN_RHS(7); { const v4f l0 = GDN_L4(7, 0); const v4f l1 = GDN_L4(7, 1); __builtin_amdgcn_sched_barrier(0); x7 -= l0.x * x0; x7 -= l0.y * x1; x7 -= l0.z * x2; x7 -= l0.w * x3; x7 -= l1.x * x4; x7 -= l1.y * x5; x7 -= l1.z * x6; } __builtin_amdgcn_sched_barrier(0);
        float x8 = GDN_RHS(8); { const v4f l0 = GDN_L4(8, 0); const v4f l1 = GDN_L4(8, 1); __builtin_amdgcn_sched_barrier(0); x8 -= l0.x * x0; x8 -= l0.y * x1; x8 -= l0.z * x2; x8 -= l0.w * x3; x8 -= l1.x * x4; x8 -= l1.y * x5; x8 -= l1.z * x6; x8 -= l1.w * x7; } __builtin_amdgcn_sched_barrier(0);
        float x9 = GDN_RHS(9); { const v4f l0 = GDN_L4(9, 0); const v4f l1 = GDN_L4(9, 1); const v4f l2 = GDN_L4(9, 2); __builtin_amdgcn_sched_barrier(0); x9 -= l0.x * x0; x9 -= l0.y * x1; x9 -= l0.z * x2; x9 -= l0.w * x3; x9 -= l1.x * x4; x9 -= l1.y * x5; x9 -= l1.z * x6; x9 -= l1.w * x7; x9 -= l2.x * x8; } __builtin_amdgcn_sched_barrier(0);
        float x10 = GDN_RHS(10); { const v4f l0 = GDN_L4(10, 0); const v4f l1 = GDN_L4(10, 1); const v4f l2 = GDN_L4(10, 2); __builtin_amdgcn_sched_barrier(0); x10 -= l0.x * x0; x10 -= l0.y * x1; x10 -= l0.z * x2; x10 -= l0.w * x3; x10 -= l1.x * x4; x10 -= l1.y * x5; x10 -= l1.z * x6; x10 -= l1.w * x7; x10 -= l2.x * x8; x10 -= l2.y * x9; } __builtin_amdgcn_sched_barrier(0);
        float x11 = GDN_RHS(11); { const v4f l0 = GDN_L4(11, 0); const v4f l1 = GDN_L4(11, 1); const v4f l2 = GDN_L4(11, 2); __builtin_amdgcn_sched_barrier(0); x11 -= l0.x * x0; x11 -= l0.y * x1; x11 -= l0.z * x2; x11 -= l0.w * x3; x11 -= l1.x * x4; x11 -= l1.y * x5; x11 -= l1.z * x6; x11 -= l1.w * x7; x11 -= l2.x * x8; x11 -= l2.y * x9; x11 -= l2.z * x10; } __builtin_amdgcn_sched_barrier(0);
        float x12 = GDN_RHS(12); { const v4f l0 = GDN_L4(12, 0); const v4f l1 = GDN_L4(12, 1); const v4f l2 = GDN_L4(12, 2); __builtin_amdgcn_sched_barrier(0); x12 -= l0.x * x0; x12 -= l0.y * x1; x12 -= l0.z * x2; x12 -= l0.w * x3; x12 -= l1.x * x4; x12 -= l1.y * x5; x12 -= l1.z * x6; x12 -= l1.w * x7; x12 -= l2.x * x8; x12 -= l2.y * x9; x12 -= l2.z * x10; x12 -= l2.w * x11; } __builtin_amdgcn_sched_barrier(0);
        float x13 = GDN_RHS(13); { const v4f l0 = GDN_L4(13, 0); const v4f l1 = GDN_L4(13, 1); const v4f l2 = GDN_L4(13, 2); const v4f l3 = GDN_L4(13, 3); __builtin_amdgcn_sched_barrier(0); x13 -= l0.x * x0; x13 -= l0.y * x1; x13 -= l0.z * x2; x13 -= l0.w * x3; x13 -= l1.x * x4; x13 -= l1.y * x5; x13 -= l1.z * x6; x13 -= l1.w * x7; x13 -= l2.x * x8; x13 -= l2.y * x9; x13 -= l2.z * x10; x13 -= l2.w * x11; x13 -= l3.x * x12; } __builtin_amdgcn_sched_barrier(0);
        float x14 = GDN_RHS(14); { const v4f l0 = GDN_L4(14, 0); const v4f l1 = GDN_L4(14, 1); const v4f l2 = GDN_L4(14, 2); const v4f l3 = GDN_L4(14, 3); __builtin_amdgcn_sched_barrier(0); x14 -= l0.x * x0; x14 -= l0.y * x1; x14 -= l0.z * x2; x14 -= l0.w * x3; x14 -= l1.x * x4; x14 -= l1.y * x5; x14 -= l1.z * x6; x14 -= l1.w * x7; x14 -= l2.x * x8; x14 -= l2.y * x9; x14 -= l2.z * x10; x14 -= l2.w * x11; x14 -= l3.x * x12; x14 -= l3.y * x13; } __builtin_amdgcn_sched_barrier(0);
        float x15 = GDN_RHS(15); { const v4f l0 = GDN_L4(15, 0); const v4f l1 = GDN_L4(15, 1); const v4f l2 = GDN_L4(15, 2); const v4f l3 = GDN_L4(15, 3); __builtin_amdgcn_sched_barrier(0); x15 -= l0.x * x0; x15 -= l0.y * x1; x15 -= l0.z * x2; x15 -= l0.w * x3; x15 -= l1.x * x4; x15 -= l1.y * x5; x15 -= l1.z * x6; x15 -= l1.w * x7; x15 -= l2.x * x8; x15 -= l2.y * x9; x15 -= l2.z * x10; x15 -= l2.w * x11; x15 -= l3.x * x12; x15 -= l3.y * x13; x15 -= l3.z * x14; } __builtin_amdgcn_sched_barrier(0);
        float x16 = GDN_RHS(16); { const v4f l0 = GDN_L4(16, 0); const v4f l1 = GDN_L4(16, 1); const v4f l2 = GDN_L4(16, 2); const v4f l3 = GDN_L4(16, 3); __builtin_amdgcn_sched_barrier(0); x16 -= l0.x * x0; x16 -= l0.y * x1; x16 -= l0.z * x2; x16 -= l0.w * x3; x16 -= l1.x * x4; x16 -= l1.y * x5; x16 -= l1.z * x6; x16 -= l1.w * x7; x16 -= l2.x * x8; x16 -= l2.y * x9; x16 -= l2.z * x10; x16 -= l2.w * x11; x16 -= l3.x * x12; x16 -= l3.y * x13; x16 -= l3.z * x14; x16 -= l3.w * x15; } __builtin_amdgcn_sched_barrier(0);
        float x17 = GDN_RHS(17); { const v4f l0 = GDN_L4(17, 0); const v4f l1 = GDN_L4(17, 1); const v4f l2 = GDN_L4(17, 2); const v4f l3 = GDN_L4(17, 3); const v4f l4 = GDN_L4(17, 4); __builtin_amdgcn_sched_barrier(0); x17 -= l0.x * x0; x17 -= l0.y * x1; x17 -= l0.z * x2; x17 -= l0.w * x3; x17 -= l1.x * x4; x17 -= l1.y * x5; x17 -= l1.z * x6; x17 -= l1.w * x7; x17 -= l2.x * x8; x17 -= l2.y * x9; x17 -= l2.z * x10; x17 -= l2.w * x11; x17 -= l3.x * x12; x17 -= l3.y * x13; x17 -= l3.z * x14; x17 -= l3.w * x15; x17 -= l4.x * x16; } __builtin_amdgcn_sched_barrier(0);
        float x18 = GDN_RHS(18); { const v4f l0 = GDN_L4(18, 0); const v4f l1 = GDN_L4(18, 1); const v4f l2 = GDN_L4(18, 2); const v4f l3 = GDN_L4(18, 3); const v4f l4 = GDN_L4(18, 4); __builtin_amdgcn_sched_barrier(0); x18 -= l0.x * x0; x18 -= l0.y * x1; x18 -= l0.z * x2; x18 -= l0.w * x3; x18 -= l1.x * x4; x18 -= l1.y * x5; x18 -= l1.z * x6; x18 -= l1.w * x7; x18 -= l2.x * x8; x18 -= l2.y * x9; x18 -= l2.z * x10; x18 -= l2.w * x11; x18 -= l3.x * x12; x18 -= l3.y * x13; x18 -= l3.z * x14; x18 -= l3.w * x15; x18 -= l4.x * x16; x18 -= l4.y * x17; } __builtin_amdgcn_sched_barrier(0);
        float x19 = GDN_RHS(19); { const v4f l0 = GDN_L4(19, 0); const v4f l1 = GDN_L4(19, 1); const v4f l2 = GDN_L4(19, 2); const v4f l3 = GDN_L4(19, 3); const v4f l4 = GDN_L4(19, 4); __builtin_amdgcn_sched_barrier(0); x19 -= l0.x * x0; x19 -= l0.y * x1; x19 -= l0.z * x2; x19 -= l0.w * x3; x19 -= l1.x * x4; x19 -= l1.y * x5; x19 -= l1.z * x6; x19 -= l1.w * x7; x19 -= l2.x * x8; x19 -= l2.y * x9; x19 -= l2.z * x10; x19 -= l2.w * x11; x19 -= l3.x * x12; x19 -= l3.y * x13; x19 -= l3.z * x14; x19 -= l3.w * x15; x19 -= l4.x * x16; x19 -= l4.y * x17; x19 -= l4.z * x18; } __builtin_amdgcn_sched_barrier(0);
        float x20 = GDN_RHS(20); { const v4f l0 = GDN_L4(20, 0); const v4f l1 = GDN_L4(20, 1); const v4f l2 = GDN_L4(20, 2); const v4f l3 = GDN_L4(20, 3); const v4f l4 = GDN_L4(20, 4); __builtin_amdgcn_sched_barrier(0); x20 -= l0.x * x0; x20 -= l0.y * x1; x20 -= l0.z * x2; x20 -= l0.w * x3; x20 -= l1.x * x4; x20 -= l1.y * x5; x20 -= l1.z * x6; x20 -= l1.w * x7; x20 -= l2.x * x8; x20 -= l2.y * x9; x20 -= l2.z * x10; x20 -= l2.w * x11; x20 -= l3.x * x12; x20 -= l3.y * x13; x20 -= l3.z * x14; x20 -= l3.w * x15; x20 -= l4.x * x16; x20 -= l4.y * x17; x20 -= l4.z * x18; x20 -= l4.w * x19; } __builtin_amdgcn_sched_barrier(0);
        float x21 = GDN_RHS(21); { const v4f l0 = GDN_L4(21, 0); const v4f l1 = GDN_L4(21, 1); const v4f l2 = GDN_L4(21, 2); const v4f l3 = GDN_L4(21, 3); const v4f l4 = GDN_L4(21, 4); const v4f l5 = GDN_L4(21, 5); __builtin_amdgcn_sched_barrier(0); x21 -= l0.x * x0; x21 -= l0.y * x1; x21 -= l0.z * x2; x21 -= l0.w * x3; x21 -= l1.x * x4; x21 -= l1.y * x5; x21 -= l1.z * x6; x21 -= l1.w * x7; x21 -= l2.x * x8; x21 -= l2.y * x9; x21 -= l2.z * x10; x21 -= l2.w * x11; x21 -= l3.x * x12; x21 -= l3.y * x13; x21 -= l3.z * x14; x21 -= l3.w * x15; x21 -= l4.x * x16; x21 -= l4.y * x17; x21 -= l4.z * x18; x21 -= l4.w * x19; x21 -= l5.x * x20; } __builtin_amdgcn_sched_barrier(0);
        float x22 = GDN_RHS(22); { const v4f l0 = GDN_L4(22, 0); const v4f l1 = GDN_L4(22, 1); const v4f l2 = GDN_L4(22, 2); const v4f l3 = GDN_L4(22, 3); const v4f l4 = GDN_L4(22, 4); const v4f l5 = GDN_L4(22, 5); __builtin_amdgcn_sched_barrier(0); x22 -= l0.x * x0; x22 -= l0.y * x1; x22 -= l0.z * x2; x22 -= l0.w * x3; x22 -= l1.x * x4; x22 -= l1.y * x5; x22 -= l1.z * x6; x22 -= l1.w * x7; x22 -= l2.x * x8; x22 -= l2.y * x9; x22 -= l2.z * x10; x22 -= l2.w * x11; x22 -= l3.x * x12; x22 -= l3.y * x13; x22 -= l3.z * x14; x22 -= l3.w * x15; x22 -= l4.x * x16; x22 -= l4.y * x17; x22 -= l4.z * x18; x22 -= l4.w * x19; x22 -= l5.x * x20; x22 -= l5.y * x21; } __builtin_amdgcn_sched_barrier(0);
        float x23 = GDN_RHS(23); { const v4f l0 = GDN_L4(23, 0); const v4f l1 = GDN_L4(23, 1); const v4f l2 = GDN_L4(23, 2); const v4f l3 = GDN_L4(23, 3); const v4f l4 = GDN_L4(23, 4); const v4f l5 = GDN_L4(23, 5); __builtin_amdgcn_sched_barrier(0); x23 -= l0.x * x0; x23 -= l0.y * x1; x23 -= l0.z * x2; x23 -= l0.w * x3; x23 -= l1.x * x4; x23 -= l1.y * x5; x23 -= l1.z * x6; x23 -= l1.w * x7; x23 -= l2.x * x8; x23 -= l2.y * x9; x23 -= l2.z * x10; x23 -= l2.w * x11; x23 -= l3.x * x12; x23 -= l3.y * x13; x23 -= l3.z * x14; x23 -= l3.w * x15; x23 -= l4.x * x16; x23 -= l4.y * x17; x23 -= l4.z * x18; x23 -= l4.w * x19; x23 -= l5.x * x20; x23 -= l5.y * x21; x23 -= l5.z * x22; } __builtin_amdgcn_sched_barrier(0);
        float x24 = GDN_RHS(24); { const v4f l0 = GDN_L4(24, 0); const v4f l1 = GDN_L4(24, 1); const v4f l2 = GDN_L4(24, 2); const v4f l3 = GDN_L4(24, 3); const v4f l4 = GDN_L4(24, 4); const v4f l5 = GDN_L4(24, 5); __builtin_amdgcn_sched_barrier(0); x24 -= l0.x * x0; x24 -= l0.y * x1; x24 -= l0.z * x2; x24 -= l0.w * x3; x24 -= l1.x * x4; x24 -= l1.y * x5; x24 -= l1.z * x6; x24 -= l1.w * x7; x24 -= l2.x * x8; x24 -= l2.y * x9; x24 -= l2.z * x10; x24 -= l2.w * x11; x24 -= l3.x * x12; x24 -= l3.y * x13; x24 -= l3.z * x14; x24 -= l3.w * x15; x24 -= l4.x * x16; x24 -= l4.y * x17; x24 -= l4.z * x18; x24 -= l4.w * x19; x24 -= l5.x * x20; x24 -= l5.y * x21; x24 -= l5.z * x22; x24 -= l5.w * x23; } __builtin_amdgcn_sched_barrier(0);
        float x25 = GDN_RHS(25); { const v4f l0 = GDN_L4(25, 0); const v4f l1 = GDN_L4(25, 1); const v4f l2 = GDN_L4(25, 2); const v4f l3 = GDN_L4(25, 3); const v4f l4 = GDN_L4(25, 4); const v4f l5 = GDN_L4(25, 5); __builtin_amdgcn_sched_barrier(0); x25 -= l0.x * x0; x25 -= l0.y * x1; x25 -= l0.z * x2; x25 -= l0.w * x3; x25 -= l1.x * x4; x25 -= l1.y * x5; x25 -= l1.z * x6; x25 -= l1.w * x7; x25 -= l2.x * x8; x25 -= l2.y * x9; x25 -= l2.z * x10; x25 -= l2.w * x11; x25 -= l3.x * x12; x25 -= l3.y * x13; x25 -= l3.z * x14; x25 -= l3.w * x15; x25 -= l4.x * x16; x25 -= l4.y * x17; x25 -= l4.z * x18; x25 -= l4.w * x19; x25 -= l5.x * x20; x25 -= l5.y * x21; x25 -= l5.z * x22; x25 -= l5.w * x23; } __builtin_amdgcn_sched_barrier(0); { const v4f l6 = GDN_L4(25, 6); __builtin_amdgcn_sched_barrier(0); x25 -= l6.x * x24; } __builtin_amdgcn_sched_barrier(0);
        float x26 = GDN_RHS(26); { const v4f l0 = GDN_L4(26, 0); const v4f l1 = GDN_L4(26, 1); const v4f l2 = GDN_L4(26, 2); const v4f l3 = GDN_L4(26, 3); const v4f l4 = GDN_L4(26, 4); const v4f l5 = GDN_L4(26, 5); __builtin_amdgcn_sched_barrier(0); x26 -= l0.x * x0; x26 -= l0.y * x1; x26 -= l0.z * x2; x26 -= l0.w * x3; x26 -= l1.x * x4; x26 -= l1.y * x5; x26 -= l1.z * x6; x26 -= l1.w * x7; x26 -= l2.x * x8; x26 -= l2.y * x9; x26 -= l2.z * x10; x26 -= l2.w * x11; x26 -= l3.x * x12; x26 -= l3.y * x13; x26 -= l3.z * x14; x26 -= l3.w * x15; x26 -= l4.x * x16; x26 -= l4.y * x17; x26 -= l4.z * x18; x26 -= l4.w * x19; x26 -= l5.x * x20; x26 -= l5.y * x21; x26 -= l5.z * x22; x26 -= l5.w * x23; } __builtin_amdgcn_sched_barrier(0); { const v4f l6 = GDN_L4(26, 6); __builtin_amdgcn_sched_barrier(0); x26 -= l6.x * x24; x26 -= l6.y * x25; } __builtin_amdgcn_sched_barrier(0);
        float x27 = GDN_RHS(27); { const v4f l0 = GDN_L4(27, 0); const v4f l1 = GDN_L4(27, 1); const v4f l2 = GDN_L4(27, 2); const v4f l3 = GDN_L4(27, 3); const v4f l4 = GDN_L4(27, 4); const v4f l5 = GDN_L4(27, 5); __builtin_amdgcn_sched_barrier(0); x27 -= l0.x * x0; x27 -= l0.y * x1; x27 -= l0.z * x2; x27 -= l0.w * x3; x27 -= l1.x * x4; x27 -= l1.y * x5; x27 -= l1.z * x6; x27 -= l1.w * x7; x27 -= l2.x * x8; x27 -= l2.y * x9; x27 -= l2.z * x10; x27 -= l2.w * x11; x27 -= l3.x * x12; x27 -= l3.y * x13; x27 -= l3.z * x14; x27 -= l3.w * x15; x27 -= l4.x * x16; x27 -= l4.y * x17; x27 -= l4.z * x18; x27 -= l4.w * x19; x27 -= l5.x * x20; x27 -= l5.y * x21; x27 -= l5.z * x22; x27 -= l5.w * x23; } __builtin_amdgcn_sched_barrier(0); { const v4f l6 = GDN_L4(27, 6); __builtin_amdgcn_sched_barrier(0); x27 -= l6.x * x24; x27 -= l6.y * x25; x27 -= l6.z * x26; } __builtin_amdgcn_sched_barrier(0);
        float x28 = GDN_RHS(28); { const v4f l0 = GDN_L4(28, 0); const v4f l1 = GDN_L4(28, 1); const v4f l2 = GDN_L4(28, 2); const v4f l3 = GDN_L4(28, 3); const v4f l4 = GDN_L4(28, 4); const v4f l5 = GDN_L4(28, 5); __builtin_amdgcn_sched_barrier(0); x28 -= l0.x * x0; x28 -= l0.y * x1; x28 -= l0.z * x2; x28 -= l0.w * x3; x28 -= l1.x * x4; x28 -= l1.y * x5; x28 -= l1.z * x6; x28 -= l1.w * x7; x28 -= l2.x * x8; x28 -= l2.y * x9; x28 -= l2.z * x10; x28 -= l2.w * x11; x28 -= l3.x * x12; x28 -= l3.y * x13; x28 -= l3.z * x14; x28 -= l3.w * x15; x28 -= l4.x * x16; x28 -= l4.y * x17; x28 -= l4.z * x18; x28 -= l4.w * x19; x28 -= l5.x * x20; x28 -= l5.y * x21; x28 -= l5.z * x22; x28 -= l5.w * x23; } __builtin_amdgcn_sched_barrier(0); { const v4f l6 = GDN_L4(28, 6); __builtin_amdgcn_sched_barrier(0); x28 -= l6.x * x24; x28 -= l6.y * x25; x28 -= l6.z * x26; x28 -= l6.w * x27; } __builtin_amdgcn_sched_barrier(0);
        float x29 = GDN_RHS(29); { const v4f l0 = GDN_L4(29, 0); const v4f l1 = GDN_L4(29, 1); const v4f l2 = GDN_L4(29, 2); const v4f l3 = GDN_L4(29, 3); const v4f l4 = GDN_L4(29, 4); const v4f l5 = GDN_L4(29, 5); __builtin_amdgcn_sched_barrier(0); x29 -= l0.x * x0; x29 -= l0.y * x1; x29 -= l0.z * x2; x29 -= l0.w * x3; x29 -= l1.x * x4; x29 -= l1.y * x5; x29 -= l1.z * x6; x29 -= l1.w * x7; x29 -= l2.x * x8; x29 -= l2.y * x9; x29 -= l2.z * x10; x29 -= l2.w * x11; x29 -= l3.x * x12; x29 -= l3.y * x13; x29 -= l3.z * x14; x29 -= l3.w * x15; x29 -= l4.x * x16; x29 -= l4.y * x17; x29 -= l4.z * x18; x29 -= l4.w * x19; x29 -= l5.x * x20; x29 -= l5.y * x21; x29 -= l5.z * x22; x29 -= l5.w * x23; } __builtin_amdgcn_sched_barrier(0); { const v4f l6 = GDN_L4(29, 6); const v4f l7 = GDN_L4(29, 7); __builtin_amdgcn_sched_barrier(0); x29 -= l6.x * x24; x29 -= l6.y * x25; x29 -= l6.z * x26; x29 -= l6.w * x27; x29 -= l7.x * x28; } __builtin_amdgcn_sched_barrier(0);
        float x30 = GDN_RHS(30); { const v4f l0 = GDN_L4(30, 0); const v4f l1 = GDN_L4(30, 1); const v4f l2 = GDN_L4(30, 2); const v4f l3 = GDN_L4(30, 3); const v4f l4 = GDN_L4(30, 4); const v4f l5 = GDN_L4(30, 5); __builtin_amdgcn_sched_barrier(0); x30 -= l0.x * x0; x30 -= l0.y * x1; x30 -= l0.z * x2; x30 -= l0.w * x3; x30 -= l1.x * x4; x30 -= l1.y * x5; x30 -= l1.z * x6; x30 -= l1.w * x7; x30 -= l2.x * x8; x30 -= l2.y * x9; x30 -= l2.z * x10; x30 -= l2.w * x11; x30 -= l3.x * x12; x30 -= l3.y * x13; x30 -= l3.z * x14; x30 -= l3.w * x15; x30 -= l4.x * x16; x30 -= l4.y * x17; x30 -= l4.z * x18; x30 -= l4.w * x19; x30 -= l5.x * x20; x30 -= l5.y * x21; x30 -= l5.z * x22; x30 -= l5.w * x23; } __builtin_amdgcn_sched_barrier(0); { const v4f l6 = GDN_L4(30, 6); const v4f l7 = GDN_L4(30, 7); __builtin_amdgcn_sched_barrier(0); x30 -= l6.x * x24; x30 -= l6.y * x25; x30 -= l6.z * x26; x30 -= l6.w * x27; x30 -= l7.x * x28; x30 -= l7.y * x29; } __builtin_amdgcn_sched_barrier(0);
        float x31 = GDN_RHS(31); { const v4f l0 = GDN_L4(31, 0); const v4f l1 = GDN_L4(31, 1); const v4f l2 = GDN_L4(31, 2); const v4f l3 = GDN_L4(31, 3); const v4f l4 = GDN_L4(31, 4); const v4f l5 = GDN_L4(31, 5); __builtin_amdgcn_sched_barrier(0); x31 -= l0.x * x0; x31 -= l0.y * x1; x31 -= l0.z * x2; x31 -= l0.w * x3; x31 -= l1.x * x4; x31 -= l1.y * x5; x31 -= l1.z * x6; x31 -= l1.w * x7; x31 -= l2.x * x8; x31 -= l2.y * x9; x31 -= l2.z * x10; x31 -= l2.w * x11; x31 -= l3.x * x12; x31 -= l3.y * x13; x31 -= l3.z * x14; x31 -= l3.w * x15; x31 -= l4.x * x16; x31 -= l4.y * x17; x31 -= l4.z * x18; x31 -= l4.w * x19; x31 -= l5.x * x20; x31 -= l5.y * x21; x31 -= l5.z * x22; x31 -= l5.w * x23; } __builtin_amdgcn_sched_barrier(0); { const v4f l6 = GDN_L4(31, 6); const v4f l7 = GDN_L4(31, 7); __builtin_amdgcn_sched_barrier(0); x31 -= l6.x * x24; x31 -= l6.y * x25; x31 -= l6.z * x26; x31 -= l6.w * x27; x31 -= l7.x * x28; x31 -= l7.y * x29; x31 -= l7.z * x30; } __builtin_amdgcn_sched_barrier(0);
        float x32 = GDN_RHS(32); { const v4f l0 = GDN_L4(32, 0); const v4f l1 = GDN_L4(32, 1); const v4f l2 = GDN_L4(32, 2); const v4f l3 = GDN_L4(32, 3); const v4f l4 = GDN_L4(32, 4); const v4f l5 = GDN_L4(32, 5); __builtin_amdgcn_sched_barrier(0); x32 -= l0.x * x0; x32 -= l0.y * x1; x32 -= l0.z * x2; x32 -= l0.w * x3; x32 -= l1.x * x4; x32 -= l1.y * x5; x32 -= l1.z * x6; x32 -= l1.w * x7; x32 -= l2.x * x8; x32 -= l2.y * x9; x32 -= l2.z * x10; x32 -= l2.w * x11; x32 -= l3.x * x12; x32 -= l3.y * x13; x32 -= l3.z * x14; x32 -= l3.w * x15; x32 -= l4.x * x16; x32 -= l4.y * x17; x32 -= l4.z * x18; x32 -= l4.w * x19; x32 -= l5.x * x20; x32 -= l5.y * x21; x32 -= l5.z * x22; x32 -= l5.w * x23; } __builtin_amdgcn_sched_barrier(0); { const v4f l6 = GDN_L4(32, 6); const v4f l7 = GDN_L4(32, 7); __builtin_amdgcn_sched_barrier(0); x32 -= l6.x * x24; x32 -= l6.y * x25; x32 -= l6.z * x26; x32 -= l6.w * x27; x32 -= l7.x * x28; x32 -= l7.y * x29; x32 -= l7.z * x30; x32 -= l7.w * x31; } __builtin_amdgcn_sched_barrier(0);
        float x33 = GDN_RHS(33); { const v4f l0 = GDN_L4(33, 0); const v4f l1 = GDN_L4(33, 1); const v4f l2 = GDN_L4(33, 2); const v4f l3 = GDN_L4(33, 3); const v4f l4 = GDN_L4(33, 4); const v4f l5 = GDN_L4(33, 5); __builtin_amdgcn_sched_barrier(0); x33 -= l0.x * x0; x33 -= l0.y * x1; x33 -= l0.z * x2; x33 -= l0.w * x3; x33 -= l1.x * x4; x33 -= l1.y * x5; x33 -= l1.z * x6; x33 -= l1.w * x7; x33 -= l2.x * x8; x33 -= l2.y * x9; x33 -= l2.z * x10; x33 -= l2.w * x11; x33 -= l3.x * x12; x33 -= l3.y * x13; x33 -= l3.z * x14; x33 -= l3.w * x15; x33 -= l4.x * x16; x33 -= l4.y * x17; x33 -= l4.z * x18; x33 -= l4.w * x19; x33 -= l5.x * x20; x33 -= l5.y * x21; x33 -= l5.z * x22; x33 -= l5.w * x23; } __builtin_amdgcn_sched_barrier(0); { const v4f l6 = GDN_L4(33, 6); const v4f l7 = GDN_L4(33, 7); const v4f l8 = GDN_L4(33, 8); __builtin_amdgcn_sched_barrier(0); x33 -= l6.x * x24; x33 -= l6.y * x25; x33 -= l6.z * x26; x33 -= l6.w * x27; x33 -= l7.x * x28; x33 -= l7.y * x29; x33 -= l7.z * x30; x33 -= l7.w * x31; x33 -= l8.x * x32; } __builtin_amdgcn_sched_barrier(0);
        float x34 = GDN_RHS(34); { const v4f l0 = GDN_L4(34, 0); const v4f l1 = GDN_L4(34, 1); const v4f l2 = GDN_L4(34, 2); const v4f l3 = GDN_L4(34, 3); const v4f l4 = GDN_L4(34, 4); const v4f l5 = GDN_L4(34, 5); __builtin_amdgcn_sched_barrier(0); x34 -= l0.x * x0; x34 -= l0.y * x1; x34 -= l0.z * x2; x34 -= l0.w * x3; x34 -= l1.x * x4; x34 -= l1.y * x5; x34 -= l1.z * x6; x34 -= l1.w * x7; x34 -= l2.x * x8; x34 -= l2.y * x9; x34 -= l2.z * x10; x34 -= l2.w * x11; x34 -= l3.x * x12; x34 -= l3.y * x13; x34 -= l3.z * x14; x34 -= l3.w * x15; x34 -= l4.x * x16; x34 -= l4.y * x17; x34 -= l4.z * x18; x34 -= l4.w * x19; x34 -= l5.x * x20; x34 -= l5.y * x21; x34 -= l5.z * x22; x34 -= l5.w * x23; } __builtin_amdgcn_sched_barrier(0); { const v4f l6 = GDN_L4(34, 6); const v4f l7 = GDN_L4(34, 7); const v4f l8 = GDN_L4(34, 8); __builtin_amdgcn_sched_barrier(0); x34 -= l6.x * x24; x34 -= l6.y * x25; x34 -= l6.z * x26; x34 -= l6.w * x27; x34 -= l7.x * x28; x34 -= l7.y * x29; x34 -= l7.z * x30; x34 -= l7.w * x31; x34 -= l8.x * x32; x34 -= l8.y * x33; } __builtin_amdgcn_sched_barrier(0);
        float x35 = GDN_RHS(35); { const v4f l0 = GDN_L4(35, 0); const v4f l1 = GDN_L4(35, 1); const v4f l2 = GDN_L4(35, 2); const v4f l3 = GDN_L4(35, 3); const v4f l4 = GDN_L4(35, 4); const v4f l5 = GDN_L4(35, 5); __builtin_amdgcn_sched_barrier(0); x35 -= l0.x * x0; x35 -= l0.y * x1; x35 -= l0.z * x2; x35 -= l0.w * x3; x35 -= l1.x * x4; x35 -= l1.y * x5; x35 -= l1.z * x6; x35 -= l1.w * x7; x35 -= l2.x * x8; x35 -= l2.y * x9; x35 -= l2.z * x10; x35 -= l2.w * x11; x35 -= l3.x * x12; x35 -= l3.y * x13; x35 -= l3.z * x14; x35 -= l3.w * x15; x35 -= l4.x * x16; x35 -= l4.y * x17; x35 -= l4.z * x18; x35 -= l4.w * x19; x35 -= l5.x * x20; x35 -= l5.y * x21; x35 -= l5.z * x22; x35 -= l5.w * x23; } __builtin_amdgcn_sched_barrier(0); { const v4f l6 = GDN_L4(35, 6); const v4f l7 = GDN_L4(35, 7); const v4f l8 = GDN_L4(35, 8); __builtin_amdgcn_sched_barrier(0); x35 -= l6.x * x24; x35 -= l6.y * x25; x35 -= l6.z * x26; x35 -= l6.w * x27; x35 -= l7.x * x28; x35 -= l7.y * x29; x35 -= l7.z * x30; x35 -= l7.w * x31; x35 -= l8.x * x32; x35 -= l8.y * x33; x35 -= l8.z * x34; } __builtin_amdgcn_sched_barrier(0);
        float x36 = GDN_RHS(36); { const v4f l0 = GDN_L4(36, 0); const v4f l1 = GDN_L4(36, 1); const v4f l2 = GDN_L4(36, 2); const v4f l3 = GDN_L4(36, 3); const v4f l4 = GDN_L4(36, 4); const v4f l5 = GDN_L4(36, 5); __builtin_amdgcn_sched_barrier(0); x36 -= l0.x * x0; x36 -= l0.y * x1; x36 -= l0.z * x2; x36 -= l0.w * x3; x36 -= l1.x * x4; x36 -= l1.y * x5; x36 -= l1.z * x6; x36 -= l1.w * x7; x36 -= l2.x * x8; x36 -= l2.y * x9; x36 -= l2.z * x10; x36 -= l2.w * x11; x36 -= l3.x * x12; x36 -= l3.y * x13; x36 -= l3.z * x14; x36 -= l3.w * x15; x36 -= l4.x * x16; x36 -= l4.y * x17; x36 -= l4.z * x18; x36 -= l4.w * x19; x36 -= l5.x * x20; x36 -= l5.y * x21; x36 -= l5.z * x22; x36 -= l5.w * x23; } __builtin_amdgcn_sched_barrier(0); { const v4f l6 = GDN_L4(36, 6); const v4f l7 = GDN_L4(36, 7); const v4f l8 = GDN_L4(36, 8); __builtin_amdgcn_sched_barrier(0); x36 -= l6.x * x24; x36 -= l6.y * x25; x36 -= l6.z * x26; x36 -= l6.w * x27; x36 -= l7.x * x28; x36 -= l7.y * x29; x36 -= l7.z * x30; x36 -= l7.w * x31; x36 -= l8.x * x32; x36 -= l8.y * x33; x36 -= l8.z * x34; x36 -= l8.w * x35; } __builtin_amdgcn_sched_barrier(0);
        float x37 = GDN_RHS(37); { const v4f l0 = GDN_L4(37, 0); const v4f l1 = GDN_L4(37, 1); const v4f l2 = GDN_L4(37, 2); const v4f l3 = GDN_L4(37, 3); const v4f l4 = GDN_L4(37, 4); const v4f l5 = GDN_L4(37, 5); __builtin_amdgcn_sched_barrier(0); x37 -= l0.x * x0; x37 -= l0.y * x1; x37 -= l0.z * x2; x37 -= l0.w * x3; x37 -= l1.x * x4; x37 -= l1.y * x5; x37 -= l1.z * x6; x37 -= l1.w * x7; x37 -= l2.x * x8; x37 -= l2.y * x9; x37 -= l2.z * x10; x37 -= l2.w * x11; x37 -= l3.x * x12; x37 -= l3.y * x13; x37 -= l3.z * x14; x37 -= l3.w * x15; x37 -= l4.x * x16; x37 -= l4.y * x17; x37 -= l4.z * x18; x37 -= l4.w * x19; x37 -= l5.x * x20; x37 -= l5.y * x21; x37 -= l5.z * x22; x37 -= l5.w * x23; } __builtin_amdgcn_sched_barrier(0); { const v4f l6 = GDN_L4(37, 6); const v4f l7 = GDN_L4(37, 7); const v4f l8 = GDN_L4(37, 8); const v4f l9 = GDN_L4(37, 9); __builtin_amdgcn_sched_barrier(0); x37 -= l6.x * x24; x37 -= l6.y * x25; x37 -= l6.z * x26; x37 -= l6.w * x27; x37 -= l7.x * x28; x37 -= l7.y * x29; x37 -= l7.z * x30; x37 -= l7.w * x31; x37 -= l8.x * x32; x37 -= l8.y * x33; x37 -= l8.z * x34; x37 -= l8.w * x35; x37 -= l9.x * x36; } __builtin_amdgcn_sched_barrier(0);
        float x38 = GDN_RHS(38); { const v4f l0 = GDN_L4(38, 0); const v4f l1 = GDN_L4(38, 1); const v4f l2 = GDN_L4(38, 2); const v4f l3 = GDN_L4(38, 3); const v4f l4 = GDN_L4(38, 4); const v4f l5 = GDN_L4(38, 5); __builtin_amdgcn_sched_barrier(0); x38 -= l0.x * x0; x38 -= l0.y * x1; x38 -= l0.z * x2; x38 -= l0.w * x3; x38 -= l1.x * x4; x38 -= l1.y * x5; x38 -= l1.z * x6; x38 -= l1.w * x7; x38 -= l2.x * x8; x38 -= l2.y * x9; x38 -= l2.z * x10; x38 -= l2.w * x11; x38 -= l3.x * x12; x38 -= l3.y * x13; x38 -= l3.z * x14; x38 -= l3.w * x15; x38 -= l4.x * x16; x38 -= l4.y * x17; x38 -= l4.z * x18; x38 -= l4.w * x19; x38 -= l5.x * x20; x38 -= l5.y * x21; x38 -= l5.z * x22; x38 -= l5.w * x23; } __builtin_amdgcn_sched_barrier(0); { const v4f l6 = GDN_L4(38, 6); const v4f l7 = GDN_L4(38, 7); const v4f l8 = GDN_L4(38, 8); const v4f l9 = GDN_L4(38, 9); __builtin_amdgcn_sched_barrier(0); x38 -= l6.x * x24; x38 -= l6.y * x25; x38 -= l6.z * x26; x38 -= l6.w * x27; x38 -= l7.x * x28; x38 -= l7.y * x29; x38 -= l7.z * x30; x38 -= l7.w * x31; x38 -= l8.x * x32; x38 -= l8.y * x33; x38 -= l8.z * x34; x38 -= l8.w * x35; x38 -= l9.x * x36; x38 -= l9.y * x37; } __builtin_amdgcn_sched_barrier(0);
        float x39 = GDN_RHS(39); { const v4f l0 = GDN_L4(39, 0); const v4f l1 = GDN_L4(39, 1); const v4f l2 = GDN_L4(39, 2); const v4f l3 = GDN_L4(39, 3); const v4f l4 = GDN_L4(39, 4); const v4f l5 = GDN_L4(39, 5); __builtin_amdgcn_sched_barrier(0); x39 -= l0.x * x0; x39 -= l0.y * x1; x39 -= l0.z * x2; x39 -= l0.w * x3; x39 -= l1.x * x4; x39 -= l1.y * x5; x39 -= l1.z * x6; x39 -= l1.w * x7; x39 -= l2.x * x8; x39 -= l2.y * x9; x39 -= l2.z * x10; x39 -= l2.w * x11; x39 -= l3.x * x12; x39 -= l3.y * x13; x39 -= l3.z * x14; x39 -= l3.w * x15; x39 -= l4.x * x16; x39 -= l4.y * x17; x39 -= l4.z * x18; x39 -= l4.w * x19; x39 -= l5.x * x20; x39 -= l5.y * x21; x39 -= l5.z * x22; x39 -= l5.w * x23; } __builtin_amdgcn_sched_barrier(0); { const v4f l6 = GDN_L4(39, 6); const v4f l7 = GDN_L4(39, 7); const v4f l8 = GDN_L4(39, 8); const v4f l9 = GDN_L4(39, 9); __builtin_amdgcn_sched_barrier(0); x39 -= l6.x * x24; x39 -= l6.y * x25; x39 -= l6.z * x26; x39 -= l6.w * x27; x39 -= l7.x * x28; x39 -= l7.y * x29; x39 -= l7.z * x30; x39 -= l7.w * x31; x39 -= l8.x * x32; x39 -= l8.y * x33; x39 -= l8.z * x34; x39 -= l8.w * x35; x39 -= l9.x * x36; x39 -= l9.y * x37; x39 -= l9.z * x38; } __builtin_amdgcn_sched_barrier(0);
        float x40 = GDN_RHS(40); { const v4f l0 = GDN_L4(40, 0); const v4f l1 = GDN_L4(40, 1); const v4f l2 = GDN_L4(40, 2); const v4f l3 = GDN_L4(40, 3); const v4f l4 = GDN_L4(40, 4); const v4f l5 = GDN_L4(40, 5); __builtin_amdgcn_sched_barrier(0); x40 -= l0.x * x0; x40 -= l0.y * x1; x40 -= l0.z * x2; x40 -= l0.w * x3; x40 -= l1.x * x4; x40 -= l1.y * x5; x40 -= l1.z * x6; x40 -= l1.w * x7; x40 -= l2.x * x8; x40 -= l2.y * x9; x40 -= l2.z * x10; x40 -= l2.w * x11; x40 -= l3.x * x12; x40 -= l3.y * x13; x40 -= l3.z * x14; x40 -= l3.w * x15; x40 -= l4.x * x16; x40 -= l4.y * x17; x40 -= l4.z * x18; x40 -= l4.w * x19; x40 -= l5.x * x20; x40 -= l5.y * x21; x40 -= l5.z * x22; x40 -= l5.w * x23; } __builtin_amdgcn_sched_barrier(0); { const v4f l6 = GDN_L4(40, 6); const v4f l7 = GDN_L4(40, 7); const v4f l8 = GDN_L4(40, 8); const v4f l9 = GDN_L4(40, 9); __builtin_amdgcn_sched_barrier(0); x40 -= l6.x * x24; x40 -= l6.y * x25; x40 -= l6.z * x26; x40 -= l6.w * x27; x40 -= l7.x * x28; x40 -= l7.y * x29; x40 -= l7.z * x30; x40 -= l7.w * x31; x40 -= l8.x * x32; x40 -= l8.y * x33; x40 -= l8.z * x34; x40 -= l8.w * x35; x40 -= l9.x * x36; x40 -= l9.y * x37; x40 -= l9.z * x38; x40 -= l9.w * x39; } __builtin_amdgcn_sched_barrier(0);
        float x41 = GDN_RHS(41); { const v4f l0 = GDN_L4(41, 0); const v4f l1 = GDN_L4(41, 1); const v4f l2 = GDN_L4(41, 2); const v4f l3 = GDN_L4(41, 3); const v4f l4 = GDN_L4(41, 4); const v4f l5 = GDN_L4(41, 5); __builtin_amdgcn_sched_barrier(0); x41 -= l0.x * x0; x41 -= l0.y * x1; x41 -= l0.z * x2; x41 -= l0.w * x3; x41 -= l1.x * x4; x41 -= l1.y * x5; x41 -= l1.z * x6; x41 -= l1.w * x7; x41 -= l2.x * x8; x41 -= l2.y * x9; x41 -= l2.z * x10; x41 -= l2.w * x11; x41 -= l3.x * x12; x41 -= l3.y * x13; x41 -= l3.z * x14; x41 -= l3.w * x15; x41 -= l4.x * x16; x41 -= l4.y * x17; x41 -= l4.z * x18; x41 -= l4.w * x19; x41 -= l5.x * x20; x41 -= l5.y * x21; x41 -= l5.z * x22; x41 -= l5.w * x23; } __builtin_amdgcn_sched_barrier(0); { const v4f l6 = GDN_L4(41, 6); const v4f l7 = GDN_L4(41, 7); const v4f l8 = GDN_L4(41, 8); const v4f l9 = GDN_L4(41, 9); const v4f l10 = GDN_L4(41, 10); __builtin_amdgcn_sched_barrier(0); x41 -= l6.x * x24; x41 -= l6.y * x25; x41 -= l6.z * x26; x41 -= l6.w * x27; x41 -= l7.x * x28; x41 -= l7.y * x29; x41 -= l7.z * x30; x41 -= l7.w * x31; x41 -= l8.x * x32; x41 -= l8.y * x33; x41 -= l8.z * x34; x41 -= l8.w * x35; x41 -= l9.x * x36; x41 -= l9.y * x37; x41 -= l9.z * x38; x41 -= l9.w * x39; x41 -= l10.x * x40; } __builtin_amdgcn_sched_barrier(0);
        float x42 = GDN_RHS(42); { const v4f l0 = GDN_L4(42, 0); const v4f l1 = GDN_L4(42, 1); const v4f l2 = GDN_L4(42, 2); const v4f l3 = GDN_L4(42, 3); const v4f l4 = GDN_L4(42, 4); const v4f l5 = GDN_L4(42, 5); __builtin_amdgcn_sched_barrier(0); x42 -= l0.x * x0; x42 -= l0.y * x1; x42 -= l0.z * x2; x42 -= l0.w * x3; x42 -= l1.x * x4; x42 -= l1.y * x5; x42 -= l1.z * x6; x42 -= l1.w * x7; x42 -= l2.x * x8; x42 -= l2.y * x9; x42 -= l2.z * x10; x42 -= l2.w * x11; x42 -= l3.x * x12; x42 -= l3.y * x13; x42 -= l3.z * x14; x42 -= l3.w * x15; x42 -= l4.x * x16; x42 -= l4.y * x17; x42 -= l4.z * x18; x42 -= l4.w * x19; x42 -= l5.x * x20; x42 -= l5.y * x21; x42 -= l5.z * x22; x42 -= l5.w * x23; } __builtin_amdgcn_sched_barrier(0); { const v4f l6 = GDN_L4(42, 6); const v4f l7 = GDN_L4(42, 7); const v4f l8 = GDN_L4(42, 8); const v4f l9 = GDN_L4(42, 9); const v4f l10 = GDN_L4(42, 10); __builtin_amdgcn_sched_barrier(0); x42 -= l6.x * x24; x42 -= l6.y * x25; x42 -= l6.z * x26; x42 -= l6.w * x27; x42 -= l7.x * x28; x42 -= l7.y * x29; x42 -= l7.z * x30; x42 -= l7.w * x31; x42 -= l8.x * x32; x42 -= l8.y * x33; x42 -= l8.z * x34; x42 -= l8.w * x35; x42 -= l9.x * x36; x42 -= l9.y * x37; x42 -= l9.z * x38; x42 -= l9.w * x39; x42 -= l10.x * x40; x42 -= l10.y * x41; } __builtin_amdgcn_sched_barrier(0);
        float x43 = GDN_RHS(43); { const v4f l0 = GDN_L4(43, 0); const v4f l1 = GDN_L4(43, 1); const v4f l2 = GDN_L4(43, 2); const v4f l3 = GDN_L4(43, 3); const v4f l4 = GDN_L4(43, 4); const v4f l5 = GDN_L4(43, 5); __builtin_amdgcn_sched_barrier(0); x43 -= l0.x * x0; x43 -= l0.y * x1; x43 -= l0.z * x2; x43 -= l0.w * x3; x43 -= l1.x * x4; x43 -= l1.y * x5; x43 -= l1.z * x6; x43 -= l1.w * x7; x43 -= l2.x * x8; x43 -= l2.y * x9; x43 -= l2.z * x10; x43 -= l2.w * x11; x43 -= l3.x * x12; x43 -= l3.y * x13; x43 -= l3.z * x14; x43 -= l3.w * x15; x43 -= l4.x * x16; x43 -= l4.y * x17; x43 -= l4.z * x18; x43 -= l4.w * x19; x43 -= l5.x * x20; x43 -= l5.y * x21; x43 -= l5.z * x22; x43 -= l5.w * x23; } __builtin_amdgcn_sched_barrier(0); { const v4f l6 = GDN_L4(43, 6); const v4f l7 = GDN_L4(43, 7); const v4f l8 = GDN_L4(43, 8); const v4f l9 = GDN_L4(43, 9); const v4f l10 = GDN_L4(43, 10); __builtin_amdgcn_sched_barrier(0); x43 -= l6.x * x24; x43 -= l6.y * x25; x43 -= l6.z * x26; x43 -= l6.w * x27; x43 -= l7.x * x28; x43 -= l7.y * x29; x43 -= l7.z * x30; x43 -= l7.w * x31; x43 -= l8.x * x32; x43 -= l8.y * x33; x43 -= l8.z * x34; x43 -= l8.w * x35; x43 -= l9.x * x36; x43 -= l9.y * x37; x43 -= l9.z * x38; x43 -= l9.w * x39; x43 -= l10.x * x40; x43 -= l10.y * x41; x43 -= l10.z * x42; } __builtin_amdgcn_sched_barrier(0);
        float x44 = GDN_RHS(44); { const v4f l0 = GDN_L4(44, 0); const v4f l1 = GDN_L4(44, 1); const v4f l2 = GDN_L4(44, 2); const v4f l3 = GDN_L4(44, 3); const v4f l4 = GDN_L4(44, 4); const v4f l5 = GDN_L4(44, 5); __builtin_amdgcn_sched_barrier(0); x44 -= l0.x * x0; x44 -= l0.y * x1; x44 -= l0.z * x2; x44 -= l0.w * x3; x44 -= l1.x * x4; x44 -= l1.y * x5; x44 -= l1.z * x6; x44 -= l1.w * x7; x44 -= l2.x * x8; x44 -= l2.y * x9; x44 -= l2.z * x10; x44 -= l2.w * x11; x44 -= l3.x * x12; x44 -= l3.y * x13; x44 -= l3.z * x14; x44 -= l3.w * x15; x44 -= l4.x * x16; x44 -= l4.y * x17; x44 -= l4.z * x18; x44 -= l4.w * x19; x44 -= l5.x * x20; x44 -= l5.y * x21; x44 -= l5.z * x22; x44 -= l5.w * x23; } __builtin_amdgcn_sched_barrier(0); { const v4f l6 = GDN_L4(44, 6); const v4f l7 = GDN_L4(44, 7); const v4f l8 = GDN_L4(44, 8); const v4f l9 = GDN_L4(44, 9); const v4f l10 = GDN_L4(44, 10); __builtin_amdgcn_sched_barrier(0); x44 -= l6.x * x24; x44 -= l6.y * x25; x44 -= l6.z * x26; x44 -= l6.w * x27; x44 -= l7.x * x28; x44 -= l7.y * x29; x44 -= l7.z * x30; x44 -= l7.w * x31; x44 -= l8.x * x32; x44 -= l8.y * x33; x44 -= l8.z * x34; x44 -= l8.w * x35; x44 -= l9.x * x36; x44 -= l9.y * x37; x44 -= l9.z * x38; x44 -= l9.w * x39; x44 -= l10.x * x40; x44 -= l10.y * x41; x44 -= l10.z * x42; x44 -= l10.w * x43; } __builtin_amdgcn_sched_barrier(0);
        float x45 = GDN_RHS(45); { const v4f l0 = GDN_L4(45, 0); const v4f l1 = GDN_L4(45, 1); const v4f l2 = GDN_L4(45, 2); const v4f l3 = GDN_L4(45, 3); const v4f l4 = GDN_L4(45, 4); const v4f l5 = GDN_L4(45, 5); __builtin_amdgcn_sched_barrier(0); x45 -= l0.x * x0; x45 -= l0.y * x1; x45 -= l0.z * x2; x45 -= l0.w * x3; x45 -= l1.x * x4; x45 -= l1.y * x5; x45 -= l1.z * x6; x45 -= l1.w * x7; x45 -= l2.x * x8; x45 -= l2.y * x9; x45 -= l2.z * x10; x45 -= l2.w * x11; x45 -= l3.x * x12; x45 -= l3.y * x13; x45 -= l3.z * x14; x45 -= l3.w * x15; x45 -= l4.x * x16; x45 -= l4.y * x17; x45 -= l4.z * x18; x45 -= l4.w * x19; x45 -= l5.x * x20; x45 -= l5.y * x21; x45 -= l5.z * x22; x45 -= l5.w * x23; } __builtin_amdgcn_sched_barrier(0); { const v4f l6 = GDN_L4(45, 6); const v4f l7 = GDN_L4(45, 7); const v4f l8 = GDN_L4(45, 8); const v4f l9 = GDN_L4(45, 9); const v4f l10 = GDN_L4(45, 10); const v4f l11 = GDN_L4(45, 11); __builtin_amdgcn_sched_barrier(0); x45 -= l6.x * x24; x45 -= l6.y * x25; x45 -= l6.z * x26; x45 -= l6.w * x27; x45 -= l7.x * x28; x45 -= l7.y * x29; x45 -= l7.z * x30; x45 -= l7.w * x31; x45 -= l8.x * x32; x45 -= l8.y * x33; x45 -= l8.z * x34; x45 -= l8.w * x35; x45 -= l9.x * x36; x45 -= l9.y * x37; x45 -= l9.z * x38; x45 -= l9.w * x39; x45 -= l10.x * x40; x45 -= l10.y * x41; x45 -= l10.z * x42; x45 -= l10.w * x43; x45 -= l11.x * x44; } __builtin_amdgcn_sched_barrier(0);
        float x46 = GDN_RHS(46); { const v4f l0 = GDN_L4(46, 0); const v4f l1 = GDN_L4(46, 1); const v4f l2 = GDN_L4(46, 2); const v4f l3 = GDN_L4(46, 3); const v4f l4 = GDN_L4(46, 4); const v4f l5 = GDN_L4(46, 5); __builtin_amdgcn_sched_barrier(0); x46 -= l0.x * x0; x46 -= l0.y * x1; x46 -= l0.z * x2; x46 -= l0.w * x3; x46 -= l1.x * x4; x46 -= l1.y * x5; x46 -= l1.z * x6; x46 -= l1.w * x7; x46 -= l2.x * x8; x46 -= l2.y * x9; x46 -= l2.z * x10; x46 -= l2.w * x11; x46 -= l3.x * x12; x46 -= l3.y * x13; x46 -= l3.z * x14; x46 -= l3.w * x15; x46 -= l4.x * x16; x46 -= l4.y * x17; x46 -= l4.z * x18; x46 -= l4.w * x19; x46 -= l5.x * x20; x46 -= l5.y * x21; x46 -= l5.z * x22; x46 -= l5.w * x23; } __builtin_amdgcn_sched_barrier(0); { const v4f l6 = GDN_L4(46, 6); const v4f l7 = GDN_L4(46, 7); const v4f l8 = GDN_L4(46, 8); const v4f l9 = GDN_L4(46, 9); const v4f l10 = GDN_L4(46, 10); const v4f l11 = GDN_L4(46, 11); __builtin_amdgcn_sched_barrier(0); x46 -= l6.x * x24; x46 -= l6.y * x25; x46 -= l6.z * x26; x46 -= l6.w * x27; x46 -= l7.x * x28; x46 -= l7.y * x29; x46 -= l7.z * x30; x46 -= l7.w * x31; x46 -= l8.x * x32; x46 -= l8.y * x33; x46 -= l8.z * x34; x46 -= l8.w * x35; x46 -= l9.x * x36; x46 -= l9.y * x37; x46 -= l9.z * x38; x46 -= l9.w * x39; x46 -= l10.x * x40; x46 -= l10.y * x41; x46 -= l10.z * x42; x46 -= l10.w * x43; x46 -= l11.x * x44; x46 -= l11.y * x45; } __builtin_amdgcn_sched_barrier(0);
        float x47 = GDN_RHS(47); { const v4f l0 = GDN_L4(47, 0); const v4f l1 = GDN_L4(47, 1); const v4f l2 = GDN_L4(47, 2); const v4f l3 = GDN_L4(47, 3); const v4f l4 = GDN_L4(47, 4); const v4f l5 = GDN_L4(47, 5); __builtin_amdgcn_sched_barrier(0); x47 -= l0.x * x0; x47 -= l0.y * x1; x47 -= l0.z * x2; x47 -= l0.w * x3; x47 -= l1.x * x4; x47 -= l1.y * x5; x47 -= l1.z * x6; x47 -= l1.w * x7; x47 -= l2.x * x8; x47 -= l2.y * x9; x47 -= l2.z * x10; x47 -= l2.w * x11; x47 -= l3.x * x12; x47 -= l3.y * x13; x47 -= l3.z * x14; x47 -= l3.w * x15; x47 -= l4.x * x16; x47 -= l4.y * x17; x47 -= l4.z * x18; x47 -= l4.w * x19; x47 -= l5.x * x20; x47 -= l5.y * x21; x47 -= l5.z * x22; x47 -= l5.w * x23; } __builtin_amdgcn_sched_barrier(0); { const v4f l6 = GDN_L4(47, 6); const v4f l7 = GDN_L4(47, 7); const v4f l8 = GDN_L4(47, 8); const v4f l9 = GDN_L4(47, 9); const v4f l10 = GDN_L4(47, 10); const v4f l11 = GDN_L4(47, 11); __builtin_amdgcn_sched_barrier(0); x47 -= l6.x * x24; x47 -= l6.y * x25; x47 -= l6.z * x26; x47 -= l6.w * x27; x47 -= l7.x * x28; x47 -= l7.y * x29; x47 -= l7.z * x30; x47 -= l7.w * x31; x47 -= l8.x * x32; x47 -= l8.y * x33; x47 -= l8.z * x34; x47 -= l8.w * x35; x47 -= l9.x * x36; x47 -= l9.y * x37; x47 -= l9.z * x38; x47 -= l9.w * x39; x47 -= l10.x * x40; x47 -= l10.y * x41; x47 -= l10.z * x42; x47 -= l10.w * x43; x47 -= l11.x * x44; x47 -= l11.y * x45; x47 -= l11.z * x46; } __builtin_amdgcn_sched_barrier(0);
        float x48 = GDN_RHS(48); { const v4f l0 = GDN_L4(48, 0); const v4f l1 = GDN_L4(48, 1); const v4f l2 = GDN_L4(48, 2); const v4f l3 = GDN_L4(48, 3); const v4f l4 = GDN_L4(48, 4); const v4f l5 = GDN_L4(48, 5); __builtin_amdgcn_sched_barrier(0); x48 -= l0.x * x0; x48 -= l0.y * x1; x48 -= l0.z * x2; x48 -= l0.w * x3; x48 -= l1.x * x4; x48 -= l1.y * x5; x48 -= l1.z * x6; x48 -= l1.w * x7; x48 -= l2.x * x8; x48 -= l2.y * x9; x48 -= l2.z * x10; x48 -= l2.w * x11; x48 -= l3.x * x12; x48 -= l3.y * x13; x48 -= l3.z * x14; x48 -= l3.w * x15; x48 -= l4.x * x16; x48 -= l4.y * x17; x48 -= l4.z * x18; x48 -= l4.w * x19; x48 -= l5.x * x20; x48 -= l5.y * x21; x48 -= l5.z * x22; x48 -= l5.w * x23; } __builtin_amdgcn_sched_barrier(0); { const v4f l6 = GDN_L4(48, 6); const v4f l7 = GDN_L4(48, 7); const v4f l8 = GDN_L4(48, 8); const v4f l9 = GDN_L4(48, 9); const v4f l10 = GDN_L4(48, 10); const v4f l11 = GDN_L4(48, 11); __builtin_amdgcn_sched_barrier(0); x48 -= l6.x * x24; x48 -= l6.y * x25; x48 -= l6.z * x26; x48 -= l6.w * x27; x48 -= l7.x * x28; x48 -= l7.y * x29; x48 -= l7.z * x30; x48 -= l7.w * x31; x48 -= l8.x * x32; x48 -= l8.y * x33; x48 -= l8.z * x34; x48 -= l8.w * x35; x48 -= l9.x * x36; x48 -= l9.y * x37; x48 -= l9.z * x38; x48 -= l9.w * x39; x48 -= l10.x * x40; x48 -= l10.y * x41; x48 -= l10.z * x42; x48 -= l10.w * x43; x48 -= l11.x * x44; x48 -= l11.y * x45; x48 -= l11.z * x46; x48 -= l11.w * x47; } __builtin_amdgcn_sched_barrier(0);
        float x49 = GDN_RHS(49); { const v4f l0 = GDN_L4(49, 0); const v4f l1 = GDN_L4(49, 1); const v4f l2 = GDN_L4(49, 2); const v4f l3 = GDN_L4(49, 3); const v4f l4 = GDN_L4(49, 4); const v4f l5 = GDN_L4(49, 5); __builtin_amdgcn_sched_barrier(0); x49 -= l0.x * x0; x49 -= l0.y * x1; x49 -= l0.z * x2; x49 -= l0.w * x3; x49 -= l1.x * x4; x49 -= l1.y * x5; x49 -= l1.z * x6; x49 -= l1.w * x7; x49 -= l2.x * x8; x49 -= l2.y * x9; x49 -= l2.z * x10; x49 -= l2.w * x11; x49 -= l3.x * x12; x49 -= l3.y * x13; x49 -= l3.z * x14; x49 -= l3.w * x15; x49 -= l4.x * x16; x49 -= l4.y * x17; x49 -= l4.z * x18; x49 -= l4.w * x19; x49 -= l5.x * x20; x49 -= l5.y * x21; x49 -= l5.z * x22; x49 -= l5.w * x23; } __builtin_amdgcn_sched_barrier(0); { const v4f l6 = GDN_L4(49, 6); const v4f l7 = GDN_L4(49, 7); const v4f l8 = GDN_L4(49, 8); const v4f l9 = GDN_L4(49, 9); const v4f l10 = GDN_L4(49, 10); const v4f l11 = GDN_L4(49, 11); __builtin_amdgcn_sched_barrier(0); x49 -= l6.x * x24; x49 -= l6.y * x25; x49 -= l6.z * x26; x49 -= l6.w * x27; x49 -= l7.x * x28; x49 -= l7.y * x29; x49 -= l7.z * x30; x49 -= l7.w * x31; x49 -= l8.x * x32; x49 -= l8.y * x33; x49 -= l8.z * x34; x49 -= l8.w * x35; x49 -= l9.x * x36; x49 -= l9.y * x37; x49 -= l9.z * x38; x49 -= l9.w * x39; x49 -= l10.x * x40; x49 -= l10.y * x41; x49 -= l10.z * x42; x49 -= l10.w * x43; x49 -= l11.x * x44; x49 -= l11.y * x45; x49 -= l11.z * x46; x49 -= l11.w * x47; } __builtin_amdgcn_sched_barrier(0); { const v4f l12 = GDN_L4(49, 12); __builtin_amdgcn_sched_barrier(0); x49 -= l12.x * x48; } __builtin_amdgcn_sched_barrier(0);
        float x50 = GDN_RHS(50); { const v4f l0 = GDN_L4(50, 0); const v4f l1 = GDN_L4(50, 1); const v4f l2 = GDN_L4(50, 2); const v4f l3 = GDN_L4(50, 3); const v4f l4 = GDN_L4(50, 4); const v4f l5 = GDN_L4(50, 5); __builtin_amdgcn_sched_barrier(0); x50 -= l0.x * x0; x50 -= l0.y * x1; x50 -= l0.z * x2; x50 -= l0.w * x3; x50 -= l1.x * x4; x50 -= l1.y * x5; x50 -= l1.z * x6; x50 -= l1.w * x7; x50 -= l2.x * x8; x50 -= l2.y * x9; x50 -= l2.z * x10; x50 -= l2.w * x11; x50 -= l3.x * x12; x50 -= l3.y * x13; x50 -= l3.z * x14; x50 -= l3.w * x15; x50 -= l4.x * x16; x50 -= l4.y * x17; x50 -= l4.z * x18; x50 -= l4.w * x19; x50 -= l5.x * x20; x50 -= l5.y * x21; x50 -= l5.z * x22; x50 -= l5.w * x23; } __builtin_amdgcn_sched_barrier(0); { const v4f l6 = GDN_L4(50, 6); const v4f l7 = GDN_L4(50, 7); const v4f l8 = GDN_L4(50, 8); const v4f l9 = GDN_L4(50, 9); const v4f l10 = GDN_L4(50, 10); const v4f l11 = GDN_L4(50, 11); __builtin_amdgcn_sched_barrier(0); x50 -= l6.x * x24; x50 -= l6.y * x25; x50 -= l6.z * x26; x50 -= l6.w * x27; x50 -= l7.x * x28; x50 -= l7.y * x29; x50 -= l7.z * x30; x50 -= l7.w * x31; x50 -= l8.x * x32; x50 -= l8.y * x33; x50 -= l8.z * x34; x50 -= l8.w * x35; x50 -= l9.x * x36; x50 -= l9.y * x37; x50 -= l9.z * x38; x50 -= l9.w * x39; x50 -= l10.x * x40; x50 -= l10.y * x41; x50 -= l10.z * x42; x50 -= l10.w * x43; x50 -= l11.x * x44; x50 -= l11.y * x45; x50 -= l11.z * x46; x50 -= l11.w * x47; } __builtin_amdgcn_sched_barrier(0); { const v4f l12 = GDN_L4(50, 12); __builtin_amdgcn_sched_barrier(0); x50 -= l12.x * x48; x50 -= l12.y * x49; } __builtin_amdgcn_sched_barrier(0);
        float x51 = GDN_RHS(51); { const v4f l0 = GDN_L4(51, 0); const v4f l1 = GDN_L4(51, 1); const v4f l2 = GDN_L4(51, 2); const v4f l3 = GDN_L4(51, 3); const v4f l4 = GDN_L4(51, 4); const v4f l5 = GDN_L4(51, 5); __builtin_amdgcn_sched_barrier(0); x51 -= l0.x * x0; x51 -= l0.y * x1; x51 -= l0.z * x2; x51 -= l0.w * x3; x51 -= l1.x * x4; x51 -= l1.y * x5; x51 -= l1.z * x6; x51 -= l1.w * x7; x51 -= l2.x * x8; x51 -= l2.y * x9; x51 -= l2.z * x10; x51 -= l2.w * x11; x51 -= l3.x * x12; x51 -= l3.y * x13; x51 -= l3.z * x14; x51 -= l3.w * x15; x51 -= l4.x * x16; x51 -= l4.y * x17; x51 -= l4.z * x18; x51 -= l4.w * x19; x51 -= l5.x * x20; x51 -= l5.y * x21; x51 -= l5.z * x22; x51 -= l5.w * x23; } __builtin_amdgcn_sched_barrier(0); { const v4f l6 = GDN_L4(51, 6); const v4f l7 = GDN_L4(51, 7); const v4f l8 = GDN_L4(51, 8); const v4f l9 = GDN_L4(51, 9); const v4f l10 = GDN_L4(51, 10); const v4f l11 = GDN_L4(51, 11); __builtin_amdgcn_sched_barrier(0); x51 -= l6.x * x24; x51 -= l6.y * x25; x51 -= l6.z * x26; x51 -= l6.w * x27; x51 -= l7.x * x28; x51 -= l7.y * x29; x51 -= l7.z * x30; x51 -= l7.w * x31; x51 -= l8.x * x32; x51 -= l8.y * x33; x51 -= l8.z * x34; x51 -= l8.w * x35; x51 -= l9.x * x36; x51 -= l9.y * x37; x51 -= l9.z * x38; x51 -= l9.w * x39; x51 -= l10.x * x40; x51 -= l10.y * x41; x51 -= l10.z * x42; x51 -= l10.w * x43; x51 -= l11.x * x44; x51 -= l11.y * x45; x51 -= l11.z * x46; x51 -= l11.w * x47; } __builtin_amdgcn_sched_barrier(0); { const v4f l12 = GDN_L4(51, 12); __builtin_amdgcn_sched_barrier(0); x51 -= l12.x * x48; x51 -= l12.y * x49; x51 -= l12.z * x50; } __builtin_amdgcn_sched_barrier(0);
        float x52 = GDN_RHS(52); { const v4f l0 = GDN_L4(52, 0); const v4f l1 = GDN_L4(52, 1); const v4f l2 = GDN_L4(52, 2); const v4f l3 = GDN_L4(52, 3); const v4f l4 = GDN_L4(52, 4); const v4f l5 = GDN_L4(52, 5); __builtin_amdgcn_sched_barrier(0); x52 -= l0.x * x0; x52 -= l0.y * x1; x52 -= l0.z * x2; x52 -= l0.w * x3; x52 -= l1.x * x4; x52 -= l1.y * x5; x52 -= l1.z * x6; x52 -= l1.w * x7; x52 -= l2.x * x8; x52 -= l2.y * x9; x52 -= l2.z * x10; x52 -= l2.w * x11; x52 -= l3.x * x12; x52 -= l3.y * x13; x52 -= l3.z * x14; x52 -= l3.w * x15; x52 -= l4.x * x16; x52 -= l4.y * x17; x52 -= l4.z * x18; x52 -= l4.w * x19; x52 -= l5.x * x20; x52 -= l5.y * x21; x52 -= l5.z * x22; x52 -= l5.w * x23; } __builtin_amdgcn_sched_barrier(0); { const v4f l6 = GDN_L4(52, 6); const v4f l7 = GDN_L4(52, 7); const v4f l8 = GDN_L4(52, 8); const v4f l9 = GDN_L4(52, 9); const v4f l10 = GDN_L4(52, 10); const v4f l11 = GDN_L4(52, 11); __builtin_amdgcn_sched_barrier(0); x52 -= l6.x * x24; x52 -= l6.y * x25; x52 -= l6.z * x26; x52 -= l6.w * x27; x52 -= l7.x * x28; x52 -= l7.y * x29; x52 -= l7.z * x30; x52 -= l7.w * x31; x52 -= l8.x * x32; x52 -= l8.y * x33; x52 -= l8.z * x34; x52 -= l8.w * x35; x52 -= l9.x * x36; x52 -= l9.y * x37; x52 -= l9.z * x38; x52 -= l9.w * x39; x52 -= l10.x * x40; x52 -= l10.y * x41; x52 -= l10.z * x42; x52 -= l10.w * x43; x52 -= l11.x * x44; x52 -= l11.y * x45; x52 -= l11.z * x46; x52 -= l11.w * x47; } __builtin_amdgcn_sched_barrier(0); { const v4f l12 = GDN_L4(52, 12); __builtin_amdgcn_sched_barrier(0); x52 -= l12.x * x48; x52 -= l12.y * x49; x52 -= l12.z * x50; x52 -= l12.w * x51; } __builtin_amdgcn_sched_barrier(0);
        float x53 = GDN_RHS(53); { const v4f l0 = GDN_L4(53, 0); const v4f l1 = GDN_L4(53, 1); const v4f l2 = GDN_L4(53, 2); const v4f l3 = GDN_L4(53, 3); const v4f l4 = GDN_L4(53, 4); const v4f l5 = GDN_L4(53, 5); __builtin_amdgcn_sched_barrier(0); x53 -= l0.x * x0; x53 -= l0.y * x1; x53 -= l0.z * x2; x53 -= l0.w * x3; x53 -= l1.x * x4; x53 -= l1.y * x5; x53 -= l1.z * x6; x53 -= l1.w * x7; x53 -= l2.x * x8; x53 -= l2.y * x9; x53 -= l2.z * x10; x53 -= l2.w * x11; x53 -= l3.x * x12; x53 -= l3.y * x13; x53 -= l3.z * x14; x53 -= l3.w * x15; x53 -= l4.x * x16; x53 -= l4.y * x17; x53 -= l4.z * x18; x53 -= l4.w * x19; x53 -= l5.x * x20; x53 -= l5.y * x21; x53 -= l5.z * x22; x53 -= l5.w * x23; } __builtin_amdgcn_sched_barrier(0); { const v4f l6 = GDN_L4(53, 6); const v4f l7 = GDN_L4(53, 7); const v4f l8 = GDN_L4(53, 8); const v4f l9 = GDN_L4(53, 9); const v4f l10 = GDN_L4(53, 10); const v4f l11 = GDN_L4(53, 11); __builtin_amdgcn_sched_barrier(0); x53 -= l6.x * x24; x53 -= l6.y * x25; x53 -= l6.z * x26; x53 -= l6.w * x27; x53 -= l7.x * x28; x53 -= l7.y * x29; x53 -= l7.z * x30; x53 -= l7.w * x31; x53 -= l8.x * x32; x53 -= l8.y * x33; x53 -= l8.z * x34; x53 -= l8.w * x35; x53 -= l9.x * x36; x53 -= l9.y * x37; x53 -= l9.z * x38; x53 -= l9.w * x39; x53 -= l10.x * x40; x53 -= l10.y * x41; x53 -= l10.z * x42; x53 -= l10.w * x43; x53 -= l11.x * x44; x53 -= l11.y * x45; x53 -= l11.z * x46; x53 -= l11.w * x47; } __builtin_amdgcn_sched_barrier(0); { const v4f l12 = GDN_L4(53, 12); const v4f l13 = GDN_L4(53, 13); __builtin_amdgcn_sched_barrier(0); x53 -= l12.x * x48; x53 -= l12.y * x49; x53 -= l12.z * x50; x53 -= l12.w * x51; x53 -= l13.x * x52; } __builtin_amdgcn_sched_barrier(0);
        float x54 = GDN_RHS(54); { const v4f l0 = GDN_L4(54, 0); const v4f l1 = GDN_L4(54, 1); const v4f l2 = GDN_L4(54, 2); const v4f l3 = GDN_L4(54, 3); const v4f l4 = GDN_L4(54, 4); const v4f l5 = GDN_L4(54, 5); __builtin_amdgcn_sched_barrier(0); x54 -= l0.x * x0; x54 -= l0.y * x1; x54 -= l0.z * x2; x54 -= l0.w * x3; x54 -= l1.x * x4; x54 -= l1.y * x5; x54 -= l1.z * x6; x54 -= l1.w * x7; x54 -= l2.x * x8; x54 -= l2.y * x9; x54 -= l2.z * x10; x54 -= l2.w * x11; x54 -= l3.x * x12; x54 -= l3.y * x13; x54 -= l3.z * x14; x54 -= l3.w * x15; x54 -= l4.x * x16; x54 -= l4.y * x17; x54 -= l4.z * x18; x54 -= l4.w * x19; x54 -= l5.x * x20; x54 -= l5.y * x21; x54 -= l5.z * x22; x54 -= l5.w * x23; } __builtin_amdgcn_sched_barrier(0); { const v4f l6 = GDN_L4(54, 6); const v4f l7 = GDN_L4(54, 7); const v4f l8 = GDN_L4(54, 8); const v4f l9 = GDN_L4(54, 9); const v4f l10 = GDN_L4(54, 10); const v4f l11 = GDN_L4(54, 11); __builtin_amdgcn_sched_barrier(0); x54 -= l6.x * x24; x54 -= l6.y * x25; x54 -= l6.z * x26; x54 -= l6.w * x27; x54 -= l7.x * x28; x54 -= l7.y * x29; x54 -= l7.z * x30; x54 -= l7.w * x31; x54 -= l8.x * x32; x54 -= l8.y * x33; x54 -= l8.z * x34; x54 -= l8.w * x35; x54 -= l9.x * x36; x54 -= l9.y * x37; x54 -= l9.z * x38; x54 -= l9.w * x39; x54 -= l10.x * x40; x54 -= l10.y * x41; x54 -= l10.z * x42; x54 -= l10.w * x43; x54 -= l11.x * x44; x54 -= l11.y * x45; x54 -= l11.z * x46; x54 -= l11.w * x47; } __builtin_amdgcn_sched_barrier(0); { const v4f l12 = GDN_L4(54, 12); const v4f l13 = GDN_L4(54, 13); __builtin_amdgcn_sched_barrier(0); x54 -= l12.x * x48; x54 -= l12.y * x49; x54 -= l12.z * x50; x54 -= l12.w * x51; x54 -= l13.x * x52; x54 -= l13.y * x53; } __builtin_amdgcn_sched_barrier(0);
        float x55 = GDN_RHS(55); { const v4f l0 = GDN_L4(55, 0); const v4f l1 = GDN_L4(55, 1); const v4f l2 = GDN_L4(55, 2); const v4f l3 = GDN_L4(55, 3); const v4f l4 = GDN_L4(55, 4); const v4f l5 = GDN_L4(55, 5); __builtin_amdgcn_sched_barrier(0); x55 -= l0.x * x0; x55 -= l0.y * x1; x55 -= l0.z * x2; x55 -= l0.w * x3; x55 -= l1.x * x4; x55 -= l1.y * x5; x55 -= l1.z * x6; x55 -= l1.w * x7; x55 -= l2.x * x8; x55 -= l2.y * x9; x55 -= l2.z * x10; x55 -= l2.w * x11; x55 -= l3.x * x12; x55 -= l3.y * x13; x55 -= l3.z * x14; x55 -= l3.w * x15; x55 -= l4.x * x16; x55 -= l4.y * x17; x55 -= l4.z * x18; x55 -= l4.w * x19; x55 -= l5.x * x20; x55 -= l5.y * x21; x55 -= l5.z * x22; x55 -= l5.w * x23; } __builtin_amdgcn_sched_barrier(0); { const v4f l6 = GDN_L4(55, 6); const v4f l7 = GDN_L4(55, 7); const v4f l8 = GDN_L4(55, 8); const v4f l9 = GDN_L4(55, 9); const v4f l10 = GDN_L4(55, 10); const v4f l11 = GDN_L4(55, 11); __builtin_amdgcn_sched_barrier(0); x55 -= l6.x * x24; x55 -= l6.y * x25; x55 -= l6.z * x26; x55 -= l6.w * x27; x55 -= l7.x * x28; x55 -= l7.y * x29; x55 -= l7.z * x30; x55 -= l7.w * x31; x55 -= l8.x * x32; x55 -= l8.y * x33; x55 -= l8.z * x34; x55 -= l8.w * x35; x55 -= l9.x * x36; x55 -= l9.y * x37; x55 -= l9.z * x38; x55 -= l9.w * x39; x55 -= l10.x * x40; x55 -= l10.y * x41; x55 -= l10.z * x42; x55 -= l10.w * x43; x55 -= l11.x * x44; x55 -= l11.y * x45; x55 -= l11.z * x46; x55 -= l11.w * x47; } __builtin_amdgcn_sched_barrier(0); { const v4f l12 = GDN_L4(55, 12); const v4f l13 = GDN_L4(55, 13); __builtin_amdgcn_sched_barrier(0); x55 -= l12.x * x48; x55 -= l12.y * x49; x55 -= l12.z * x50; x55 -= l12.w * x51; x55 -= l13.x * x52; x55 -= l13.y * x53; x55 -= l13.z * x54; } __builtin_amdgcn_sched_barrier(0);
        float x56 = GDN_RHS(56); { const v4f l0 = GDN_L4(56, 0); const v4f l1 = GDN_L4(56, 1); const v4f l2 = GDN_L4(56, 2); const v4f l3 = GDN_L4(56, 3); const v4f l4 = GDN_L4(56, 4); const v4f l5 = GDN_L4(56, 5); __builtin_amdgcn_sched_barrier(0); x56 -= l0.x * x0; x56 -= l0.y * x1; x56 -= l0.z * x2; x56 -= l0.w * x3; x56 -= l1.x * x4; x56 -= l1.y * x5; x56 -= l1.z * x6; x56 -= l1.w * x7; x56 -= l2.x * x8; x56 -= l2.y * x9; x56 -= l2.z * x10; x56 -= l2.w * x11; x56 -= l3.x * x12; x56 -= l3.y * x13; x56 -= l3.z * x14; x56 -= l3.w * x15; x56 -= l4.x * x16; x56 -= l4.y * x17; x56 -= l4.z * x18; x56 -= l4.w * x19; x56 -= l5.x * x20; x56 -= l5.y * x21; x56 -= l5.z * x22; x56 -= l5.w * x23; } __builtin_amdgcn_sched_barrier(0); { const v4f l6 = GDN_L4(56, 6); const v4f l7 = GDN_L4(56, 7); const v4f l8 = GDN_L4(56, 8); const v4f l9 = GDN_L4(56, 9); const v4f l10 = GDN_L4(56, 10); const v4f l11 = GDN_L4(56, 11); __builtin_amdgcn_sched_barrier(0); x56 -= l6.x * x24; x56 -= l6.y * x25; x56 -= l6.z * x26; x56 -= l6.w * x27; x56 -= l7.x * x28; x56 -= l7.y * x29; x56 -= l7.z * x30; x56 -= l7.w * x31; x56 -= l8.x * x32; x56 -= l8.y * x33; x56 -= l8.z * x34; x56 -= l8.w * x35; x56 -= l9.x * x36; x56 -= l9.y * x37; x56 -= l9.z * x38; x56 -= l9.w * x39; x56 -= l10.x * x40; x56 -= l10.y * x41; x56 -= l10.z * x42; x56 -= l10.w * x43; x56 -= l11.x * x44; x56 -= l11.y * x45; x56 -= l11.z * x46; x56 -= l11.w * x47; } __builtin_amdgcn_sched_barrier(0); { const v4f l12 = GDN_L4(56, 12); const v4f l13 = GDN_L4(56, 13); __builtin_amdgcn_sched_barrier(0); x56 -= l12.x * x48; x56 -= l12.y * x49; x56 -= l12.z * x50; x56 -= l12.w * x51; x56 -= l13.x * x52; x56 -= l13.y * x53; x56 -= l13.z * x54; x56 -= l13.w * x55; } __builtin_amdgcn_sched_barrier(0);
        float x57 = GDN_RHS(57); { const v4f l0 = GDN_L4(57, 0); const v4f l1 = GDN_L4(57, 1); const v4f l2 = GDN_L4(57, 2); const v4f l3 = GDN_L4(57, 3); const v4f l4 = GDN_L4(57, 4); const v4f l5 = GDN_L4(57, 5); __builtin_amdgcn_sched_barrier(0); x57 -= l0.x * x0; x57 -= l0.y * x1; x57 -= l0.z * x2; x57 -= l0.w * x3; x57 -= l1.x * x4; x57 -= l1.y * x5; x57 -= l1.z * x6; x57 -= l1.w * x7; x57 -= l2.x * x8; x57 -= l2.y * x9; x57 -= l2.z * x10; x57 -= l2.w * x11; x57 -= l3.x * x12; x57 -= l3.y * x13; x57 -= l3.z * x14; x57 -= l3.w * x15; x57 -= l4.x * x16; x57 -= l4.y * x17; x57 -= l4.z * x18; x57 -= l4.w * x19; x57 -= l5.x * x20; x57 -= l5.y * x21; x57 -= l5.z * x22; x57 -= l5.w * x23; } __builtin_amdgcn_sched_barrier(0); { const v4f l6 = GDN_L4(57, 6); const v4f l7 = GDN_L4(57, 7); const v4f l8 = GDN_L4(57, 8); const v4f l9 = GDN_L4(57, 9); const v4f l10 = GDN_L4(57, 10); const v4f l11 = GDN_L4(57, 11); __builtin_amdgcn_sched_barrier(0); x57 -= l6.x * x24; x57 -= l6.y * x25; x57 -= l6.z * x26; x57 -= l6.w * x27; x57 -= l7.x * x28; x57 -= l7.y * x29; x57 -= l7.z * x30; x57 -= l7.w * x31; x57 -= l8.x * x32; x57 -= l8.y * x33; x57 -= l8.z * x34; x57 -= l8.w * x35; x57 -= l9.x * x36; x57 -= l9.y * x37; x57 -= l9.z * x38; x57 -= l9.w * x39; x57 -= l10.x * x40; x57 -= l10.y * x41; x57 -= l10.z * x42; x57 -= l10.w * x43; x57 -= l11.x * x44; x57 -= l11.y * x45; x57 -= l11.z * x46; x57 -= l11.w * x47; } __builtin_amdgcn_sched_barrier(0); { const v4f l12 = GDN_L4(57, 12); const v4f l13 = GDN_L4(57, 13); const v4f l14 = GDN_L4(57, 14); __builtin_amdgcn_sched_barrier(0); x57 -= l12.x * x48; x57 -= l12.y * x49; x57 -= l12.z * x50; x57 -= l12.w * x51; x57 -= l13.x * x52; x57 -= l13.y * x53; x57 -= l13.z * x54; x57 -= l13.w * x55; x57 -= l14.x * x56; } __builtin_amdgcn_sched_barrier(0);
        float x58 = GDN_RHS(58); { const v4f l0 = GDN_L4(58, 0); const v4f l1 = GDN_L4(58, 1); const v4f l2 = GDN_L4(58, 2); const v4f l3 = GDN_L4(58, 3); const v4f l4 = GDN_L4(58, 4); const v4f l5 = GDN_L4(58, 5); __builtin_amdgcn_sched_barrier(0); x58 -= l0.x * x0; x58 -= l0.y * x1; x58 -= l0.z * x2; x58 -= l0.w * x3; x58 -= l1.x * x4; x58 -= l1.y * x5; x58 -= l1.z * x6; x58 -= l1.w * x7; x58 -= l2.x * x8; x58 -= l2.y * x9; x58 -= l2.z * x10; x58 -= l2.w * x11; x58 -= l3.x * x12; x58 -= l3.y * x13; x58 -= l3.z * x14; x58 -= l3.w * x15; x58 -= l4.x * x16; x58 -= l4.y * x17; x58 -= l4.z * x18; x58 -= l4.w * x19; x58 -= l5.x * x20; x58 -= l5.y * x21; x58 -= l5.z * x22; x58 -= l5.w * x23; } __builtin_amdgcn_sched_barrier(0); { const v4f l6 = GDN_L4(58, 6); const v4f l7 = GDN_L4(58, 7); const v4f l8 = GDN_L4(58, 8); const v4f l9 = GDN_L4(58, 9); const v4f l10 = GDN_L4(58, 10); const v4f l11 = GDN_L4(58, 11); __builtin_amdgcn_sched_barrier(0); x58 -= l6.x * x24; x58 -= l6.y * x25; x58 -= l6.z * x26; x58 -= l6.w * x27; x58 -= l7.x * x28; x58 -= l7.y * x29; x58 -= l7.z * x30; x58 -= l7.w * x31; x58 -= l8.x * x32; x58 -= l8.y * x33; x58 -= l8.z * x34; x58 -= l8.w * x35; x58 -= l9.x * x36; x58 -= l9.y * x37; x58 -= l9.z * x38; x58 -= l9.w * x39; x58 -= l10.x * x40; x58 -= l10.y * x41; x58 -= l10.z * x42; x58 -= l10.w * x43; x58 -= l11.x * x44; x58 -= l11.y * x45; x58 -= l11.z * x46; x58 -= l11.w * x47; } __builtin_amdgcn_sched_barrier(0); { const v4f l12 = GDN_L4(58, 12); const v4f l13 = GDN_L4(58, 13); const v4f l14 = GDN_L4(58, 14); __builtin_amdgcn_sched_barrier(0); x58 -= l12.x * x48; x58 -= l12.y * x49; x58 -= l12.z * x50; x58 -= l12.w * x51; x58 -= l13.x * x52; x58 -= l13.y * x53; x58 -= l13.z * x54; x58 -= l13.w * x55; x58 -= l14.x * x56; x58 -= l14.y * x57; } __builtin_amdgcn_sched_barrier(0);
        float x59 = GDN_RHS(59); { const v4f l0 = GDN_L4(59, 0); const v4f l1 = GDN_L4(59, 1); const v4f l2 = GDN_L4(59, 2); const v4f l3 = GDN_L4(59, 3); const v4f l4 = GDN_L4(59, 4); const v4f l5 = GDN_L4(59, 5); __builtin_amdgcn_sched_barrier(0); x59 -= l0.x * x0; x59 -= l0.y * x1; x59 -= l0.z * x2; x59 -= l0.w * x3; x59 -= l1.x * x4; x59 -= l1.y * x5; x59 -= l1.z * x6; x59 -= l1.w * x7; x59 -= l2.x * x8; x59 -= l2.y * x9; x59 -= l2.z * x10; x59 -= l2.w * x11; x59 -= l3.x * x12; x59 -= l3.y * x13; x59 -= l3.z * x14; x59 -= l3.w * x15; x59 -= l4.x * x16; x59 -= l4.y * x17; x59 -= l4.z * x18; x59 -= l4.w * x19; x59 -= l5.x * x20; x59 -= l5.y * x21; x59 -= l5.z * x22; x59 -= l5.w * x23; } __builtin_amdgcn_sched_barrier(0); { const v4f l6 = GDN_L4(59, 6); const v4f l7 = GDN_L4(59, 7); const v4f l8 = GDN_L4(59, 8); const v4f l9 = GDN_L4(59, 9); const v4f l10 = GDN_L4(59, 10); const v4f l11 = GDN_L4(59, 11); __builtin_amdgcn_sched_barrier(0); x59 -= l6.x * x24; x59 -= l6.y * x25; x59 -= l6.z * x26; x59 -= l6.w * x27; x59 -= l7.x * x28; x59 -= l7.y * x29; x59 -= l7.z * x30; x59 -= l7.w * x31; x59 -= l8.x * x32; x59 -= l8.y * x33; x59 -= l8.z * x34; x59 -= l8.w * x35; x59 -= l9.x * x36; x59 -= l9.y * x37; x59 -= l9.z * x38; x59 -= l9.w * x39; x59 -= l10.x * x40; x59 -= l10.y * x41; x59 -= l10.z * x42; x59 -= l10.w * x43; x59 -= l11.x * x44; x59 -= l11.y * x45; x59 -= l11.z * x46; x59 -= l11.w * x47; } __builtin_amdgcn_sched_barrier(0); { const v4f l12 = GDN_L4(59, 12); const v4f l13 = GDN_L4(59, 13); const v4f l14 = GDN_L4(59, 14); __builtin_amdgcn_sched_barrier(0); x59 -= l12.x * x48; x59 -= l12.y * x49; x59 -= l12.z * x50; x59 -= l12.w * x51; x59 -= l13.x * x52; x59 -= l13.y * x53; x59 -= l13.z * x54; x59 -= l13.w * x55; x59 -= l14.x * x56; x59 -= l14.y * x57; x59 -= l14.z * x58; } __builtin_amdgcn_sched_barrier(0);
        float x60 = GDN_RHS(60); { const v4f l0 = GDN_L4(60, 0); const v4f l1 = GDN_L4(60, 1); const v4f l2 = GDN_L4(60, 2); const v4f l3 = GDN_L4(60, 3); const v4f l4 = GDN_L4(60, 4); const v4f l5 = GDN_L4(60, 5); __builtin_amdgcn_sched_barrier(0); x60 -= l0.x * x0; x60 -= l0.y * x1; x60 -= l0.z * x2; x60 -= l0.w * x3; x60 -= l1.x * x4; x60 -= l1.y * x5; x60 -= l1.z * x6; x60 -= l1.w * x7; x60 -= l2.x * x8; x60 -= l2.y * x9; x60 -= l2.z * x10; x60 -= l2.w * x11; x60 -= l3.x * x12; x60 -= l3.y * x13; x60 -= l3.z * x14; x60 -= l3.w * x15; x60 -= l4.x * x16; x60 -= l4.y * x17; x60 -= l4.z * x18; x60 -= l4.w * x19; x60 -= l5.x * x20; x60 -= l5.y * x21; x60 -= l5.z * x22; x60 -= l5.w * x23; } __builtin_amdgcn_sched_barrier(0); { const v4f l6 = GDN_L4(60, 6); const v4f l7 = GDN_L4(60, 7); const v4f l8 = GDN_L4(60, 8); const v4f l9 = GDN_L4(60, 9); const v4f l10 = GDN_L4(60, 10); const v4f l11 = GDN_L4(60, 11); __builtin_amdgcn_sched_barrier(0); x60 -= l6.x * x24; x60 -= l6.y * x25; x60 -= l6.z * x26; x60 -= l6.w * x27; x60 -= l7.x * x28; x60 -= l7.y * x29; x60 -= l7.z * x30; x60 -= l7.w * x31; x60 -= l8.x * x32; x60 -= l8.y * x33; x60 -= l8.z * x34; x60 -= l8.w * x35; x60 -= l9.x * x36; x60 -= l9.y * x37; x60 -= l9.z * x38; x60 -= l9.w * x39; x60 -= l10.x * x40; x60 -= l10.y * x41; x60 -= l10.z * x42; x60 -= l10.w * x43; x60 -= l11.x * x44; x60 -= l11.y * x45; x60 -= l11.z * x46; x60 -= l11.w * x47; } __builtin_amdgcn_sched_barrier(0); { const v4f l12 = GDN_L4(60, 12); const v4f l13 = GDN_L4(60, 13); const v4f l14 = GDN_L4(60, 14); __builtin_amdgcn_sched_barrier(0); x60 -= l12.x * x48; x60 -= l12.y * x49; x60 -= l12.z * x50; x60 -= l12.w * x51; x60 -= l13.x * x52; x60 -= l13.y * x53; x60 -= l13.z * x54; x60 -= l13.w * x55; x60 -= l14.x * x56; x60 -= l14.y * x57; x60 -= l14.z * x58; x60 -= l14.w * x59; } __builtin_amdgcn_sched_barrier(0);
        float x61 = GDN_RHS(61); { const v4f l0 = GDN_L4(61, 0); const v4f l1 = GDN_L4(61, 1); const v4f l2 = GDN_L4(61, 2); const v4f l3 = GDN_L4(61, 3); const v4f l4 = GDN_L4(61, 4); const v4f l5 = GDN_L4(61, 5); __builtin_amdgcn_sched_barrier(0); x61 -= l0.x * x0; x61 -= l0.y * x1; x61 -= l0.z * x2; x61 -= l0.w * x3; x61 -= l1.x * x4; x61 -= l1.y * x5; x61 -= l1.z * x6; x61 -= l1.w * x7; x61 -= l2.x * x8; x61 -= l2.y * x9; x61 -= l2.z * x10; x61 -= l2.w * x11; x61 -= l3.x * x12; x61 -= l3.y * x13; x61 -= l3.z * x14; x61 -= l3.w * x15; x61 -= l4.x * x16; x61 -= l4.y * x17; x61 -= l4.z * x18; x61 -= l4.w * x19; x61 -= l5.x * x20; x61 -= l5.y * x21; x61 -= l5.z * x22; x61 -= l5.w * x23; } __builtin_amdgcn_sched_barrier(0); { const v4f l6 = GDN_L4(61, 6); const v4f l7 = GDN_L4(61, 7); const v4f l8 = GDN_L4(61, 8); const v4f l9 = GDN_L4(61, 9); const v4f l10 = GDN_L4(61, 10); const v4f l11 = GDN_L4(61, 11); __builtin_amdgcn_sched_barrier(0); x61 -= l6.x * x24; x61 -= l6.y * x25; x61 -= l6.z * x26; x61 -= l6.w * x27; x61 -= l7.x * x28; x61 -= l7.y * x29; x61 -= l7.z * x30; x61 -= l7.w * x31; x61 -= l8.x * x32; x61 -= l8.y * x33; x61 -= l8.z * x34; x61 -= l8.w * x35; x61 -= l9.x * x36; x61 -= l9.y * x37; x61 -= l9.z * x38; x61 -= l9.w * x39; x61 -= l10.x * x40; x61 -= l10.y * x41; x61 -= l10.z * x42; x61 -= l10.w * x43; x61 -= l11.x * x44; x61 -= l11.y * x45; x61 -= l11.z * x46; x61 -= l11.w * x47; } __builtin_amdgcn_sched_barrier(0); { const v4f l12 = GDN_L4(61, 12); const v4f l13 = GDN_L4(61, 13); const v4f l14 = GDN_L4(61, 14); const v4f l15 = GDN_L4(61, 15); __builtin_amdgcn_sched_barrier(0); x61 -= l12.x * x48; x61 -= l12.y * x49; x61 -= l12.z * x50; x61 -= l12.w * x51; x61 -= l13.x * x52; x61 -= l13.y * x53; x61 -= l13.z * x54; x61 -= l13.w * x55; x61 -= l14.x * x56; x61 -= l14.y * x57; x61 -= l14.z * x58; x61 -= l14.w * x59; x61 -= l15.x * x60; } __builtin_amdgcn_sched_barrier(0);
        float x62 = GDN_RHS(62); { const v4f l0 = GDN_L4(62, 0); const v4f l1 = GDN_L4(62, 1); const v4f l2 = GDN_L4(62, 2); const v4f l3 = GDN_L4(62, 3); const v4f l4 = GDN_L4(62, 4); const v4f l5 = GDN_L4(62, 5); __builtin_amdgcn_sched_barrier(0); x62 -= l0.x * x0; x62 -= l0.y * x1; x62 -= l0.z * x2; x62 -= l0.w * x3; x62 -= l1.x * x4; x62 -= l1.y * x5; x62 -= l1.z * x6; x62 -= l1.w * x7; x62 -= l2.x * x8; x62 -= l2.y * x9; x62 -= l2.z * x10; x62 -= l2.w * x11; x62 -= l3.x * x12; x62 -= l3.y * x13; x62 -= l3.z * x14; x62 -= l3.w * x15; x62 -= l4.x * x16; x62 -= l4.y * x17; x62 -= l4.z * x18; x62 -= l4.w * x19; x62 -= l5.x * x20; x62 -= l5.y * x21; x62 -= l5.z * x22; x62 -= l5.w * x23; } __builtin_amdgcn_sched_barrier(0); { const v4f l6 = GDN_L4(62, 6); const v4f l7 = GDN_L4(62, 7); const v4f l8 = GDN_L4(62, 8); const v4f l9 = GDN_L4(62, 9); const v4f l10 = GDN_L4(62, 10); const v4f l11 = GDN_L4(62, 11); __builtin_amdgcn_sched_barrier(0); x62 -= l6.x * x24; x62 -= l6.y * x25; x62 -= l6.z * x26; x62 -= l6.w * x27; x62 -= l7.x * x28; x62 -= l7.y * x29; x62 -= l7.z * x30; x62 -= l7.w * x31; x62 -= l8.x * x32; x62 -= l8.y * x33; x62 -= l8.z * x34; x62 -= l8.w * x35; x62 -= l9.x * x36; x62 -= l9.y * x37; x62 -= l9.z * x38; x62 -= l9.w * x39; x62 -= l10.x * x40; x62 -= l10.y * x41; x62 -= l10.z * x42; x62 -= l10.w * x43; x62 -= l11.x * x44; x62 -= l11.y * x45; x62 -= l11.z * x46; x62 -= l11.w * x47; } __builtin_amdgcn_sched_barrier(0); { const v4f l12 = GDN_L4(62, 12); const v4f l13 = GDN_L4(62, 13); const v4f l14 = GDN_L4(62, 14); const v4f l15 = GDN_L4(62, 15); __builtin_amdgcn_sched_barrier(0); x62 -= l12.x * x48; x62 -= l12.y * x49; x62 -= l12.z * x50; x62 -= l12.w * x51; x62 -= l13.x * x52; x62 -= l13.y * x53; x62 -= l13.z * x54; x62 -= l13.w * x55; x62 -= l14.x * x56; x62 -= l14.y * x57; x62 -= l14.z * x58; x62 -= l14.w * x59; x62 -= l15.x * x60; x62 -= l15.y * x61; } __builtin_amdgcn_sched_barrier(0);
        float x63 = GDN_RHS(63); { const v4f l0 = GDN_L4(63, 0); const v4f l1 = GDN_L4(63, 1); const v4f l2 = GDN_L4(63, 2); const v4f l3 = GDN_L4(63, 3); const v4f l4 = GDN_L4(63, 4); const v4f l5 = GDN_L4(63, 5); __builtin_amdgcn_sched_barrier(0); x63 -= l0.x * x0; x63 -= l0.y * x1; x63 -= l0.z * x2; x63 -= l0.w * x3; x63 -= l1.x * x4; x63 -= l1.y * x5; x63 -= l1.z * x6; x63 -= l1.w * x7; x63 -= l2.x * x8; x63 -= l2.y * x9; x63 -= l2.z * x10; x63 -= l2.w * x11; x63 -= l3.x * x12; x63 -= l3.y * x13; x63 -= l3.z * x14; x63 -= l3.w * x15; x63 -= l4.x * x16; x63 -= l4.y * x17; x63 -= l4.z * x18; x63 -= l4.w * x19; x63 -= l5.x * x20; x63 -= l5.y * x21; x63 -= l5.z * x22; x63 -= l5.w * x23; } __builtin_amdgcn_sched_barrier(0); { const v4f l6 = GDN_L4(63, 6); const v4f l7 = GDN_L4(63, 7); const v4f l8 = GDN_L4(63, 8); const v4f l9 = GDN_L4(63, 9); const v4f l10 = GDN_L4(63, 10); const v4f l11 = GDN_L4(63, 11); __builtin_amdgcn_sched_barrier(0); x63 -= l6.x * x24; x63 -= l6.y * x25; x63 -= l6.z * x26; x63 -= l6.w * x27; x63 -= l7.x * x28; x63 -= l7.y * x29; x63 -= l7.z * x30; x63 -= l7.w * x31; x63 -= l8.x * x32; x63 -= l8.y * x33; x63 -= l8.z * x34; x63 -= l8.w * x35; x63 -= l9.x * x36; x63 -= l9.y * x37; x63 -= l9.z * x38; x63 -= l9.w * x39; x63 -= l10.x * x40; x63 -= l10.y * x41; x63 -= l10.z * x42; x63 -= l10.w * x43; x63 -= l11.x * x44; x63 -= l11.y * x45; x63 -= l11.z * x46; x63 -= l11.w * x47; } __builtin_amdgcn_sched_barrier(0); { const v4f l12 = GDN_L4(63, 12); const v4f l13 = GDN_L4(63, 13); const v4f l14 = GDN_L4(63, 14); const v4f l15 = GDN_L4(63, 15); __builtin_amdgcn_sched_barrier(0); x63 -= l12.x * x48; x63 -= l12.y * x49; x63 -= l12.z * x50; x63 -= l12.w * x51; x63 -= l13.x * x52; x63 -= l13.y * x53; x63 -= l13.z * x54; x63 -= l13.w * x55; x63 -= l14.x * x56; x63 -= l14.y * x57; x63 -= l14.z * x58; x63 -= l14.w * x59; x63 -= l15.x * x60; x63 -= l15.y * x61; x63 -= l15.z * x62; } __builtin_amdgcn_sched_barrier(0);
        if (c < 128) { GU[0 * 128 + c] = x0; GU[1 * 128 + c] = x1; GU[2 * 128 + c] = x2; GU[3 * 128 + c] = x3; GU[4 * 128 + c] = x4; GU[5 * 128 + c] = x5; GU[6 * 128 + c] = x6; GU[7 * 128 + c] = x7; GU[8 * 128 + c] = x8; GU[9 * 128 + c] = x9; GU[10 * 128 + c] = x10; GU[11 * 128 + c] = x11; GU[12 * 128 + c] = x12; GU[13 * 128 + c] = x13; GU[14 * 128 + c] = x14; GU[15 * 128 + c] = x15; GU[16 * 128 + c] = x16; GU[17 * 128 + c] = x17; GU[18 * 128 + c] = x18; GU[19 * 128 + c] = x19; GU[20 * 128 + c] = x20; GU[21 * 128 + c] = x21; GU[22 * 128 + c] = x22; GU[23 * 128 + c] = x23; GU[24 * 128 + c] = x24; GU[25 * 128 + c] = x25; GU[26 * 128 + c] = x26; GU[27 * 128 + c] = x27; GU[28 * 128 + c] = x28; GU[29 * 128 + c] = x29; GU[30 * 128 + c] = x30; GU[31 * 128 + c] = x31; GU[32 * 128 + c] = x32; GU[33 * 128 + c] = x33; GU[34 * 128 + c] = x34; GU[35 * 128 + c] = x35; GU[36 * 128 + c] = x36; GU[37 * 128 + c] = x37; GU[38 * 128 + c] = x38; GU[39 * 128 + c] = x39; GU[40 * 128 + c] = x40; GU[41 * 128 + c] = x41; GU[42 * 128 + c] = x42; GU[43 * 128 + c] = x43; GU[44 * 128 + c] = x44; GU[45 * 128 + c] = x45; GU[46 * 128 + c] = x46; GU[47 * 128 + c] = x47; GU[48 * 128 + c] = x48; GU[49 * 128 + c] = x49; GU[50 * 128 + c] = x50; GU[51 * 128 + c] = x51; GU[52 * 128 + c] = x52; GU[53 * 128 + c] = x53; GU[54 * 128 + c] = x54; GU[55 * 128 + c] = x55; GU[56 * 128 + c] = x56; GU[57 * 128 + c] = x57; GU[58 * 128 + c] = x58; GU[59 * 128 + c] = x59; GU[60 * 128 + c] = x60; GU[61 * 128 + c] = x61; GU[62 * 128 + c] = x62; GU[63 * 128 + c] = x63; }
        else { GNW[0 * 128 + (c - 128)] = (bf16)f2bf(-x0); GNW[1 * 128 + (c - 128)] = (bf16)f2bf(-x1); GNW[2 * 128 + (c - 128)] = (bf16)f2bf(-x2); GNW[3 * 128 + (c - 128)] = (bf16)f2bf(-x3); GNW[4 * 128 + (c - 128)] = (bf16)f2bf(-x4); GNW[5 * 128 + (c - 128)] = (bf16)f2bf(-x5); GNW[6 * 128 + (c - 128)] = (bf16)f2bf(-x6); GNW[7 * 128 + (c - 128)] = (bf16)f2bf(-x7); GNW[8 * 128 + (c - 128)] = (bf16)f2bf(-x8); GNW[9 * 128 + (c - 128)] = (bf16)f2bf(-x9); GNW[10 * 128 + (c - 128)] = (bf16)f2bf(-x10); GNW[11 * 128 + (c - 128)] = (bf16)f2bf(-x11); GNW[12 * 128 + (c - 128)] = (bf16)f2bf(-x12); GNW[13 * 128 + (c - 128)] = (bf16)f2bf(-x13); GNW[14 * 128 + (c - 128)] = (bf16)f2bf(-x14); GNW[15 * 128 + (c - 128)] = (bf16)f2bf(-x15); GNW[16 * 128 + (c - 128)] = (bf16)f2bf(-x16); GNW[17 * 128 + (c - 128)] = (bf16)f2bf(-x17); GNW[18 * 128 + (c - 128)] = (bf16)f2bf(-x18); GNW[19 * 128 + (c - 128)] = (bf16)f2bf(-x19); GNW[20 * 128 + (c - 128)] = (bf16)f2bf(-x20); GNW[21 * 128 + (c - 128)] = (bf16)f2bf(-x21); GNW[22 * 128 + (c - 128)] = (bf16)f2bf(-x22); GNW[23 * 128 + (c - 128)] = (bf16)f2bf(-x23); GNW[24 * 128 + (c - 128)] = (bf16)f2bf(-x24); GNW[25 * 128 + (c - 128)] = (bf16)f2bf(-x25); GNW[26 * 128 + (c - 128)] = (bf16)f2bf(-x26); GNW[27 * 128 + (c - 128)] = (bf16)f2bf(-x27); GNW[28 * 128 + (c - 128)] = (bf16)f2bf(-x28); GNW[29 * 128 + (c - 128)] = (bf16)f2bf(-x29); GNW[30 * 128 + (c - 128)] = (bf16)f2bf(-x30); GNW[31 * 128 + (c - 128)] = (bf16)f2bf(-x31); GNW[32 * 128 + (c - 128)] = (bf16)f2bf(-x32); GNW[33 * 128 + (c - 128)] = (bf16)f2bf(-x33); GNW[34 * 128 + (c - 128)] = (bf16)f2bf(-x34); GNW[35 * 128 + (c - 128)] = (bf16)f2bf(-x35); GNW[36 * 128 + (c - 128)] = (bf16)f2bf(-x36); GNW[37 * 128 + (c - 128)] = (bf16)f2bf(-x37); GNW[38 * 128 + (c - 128)] = (bf16)f2bf(-x38); GNW[39 * 128 + (c - 128)] = (bf16)f2bf(-x39); GNW[40 * 128 + (c - 128)] = (bf16)f2bf(-x40); GNW[41 * 128 + (c - 128)] = (bf16)f2bf(-x41); GNW[42 * 128 + (c - 128)] = (bf16)f2bf(-x42); GNW[43 * 128 + (c - 128)] = (bf16)f2bf(-x43); GNW[44 * 128 + (c - 128)] = (bf16)f2bf(-x44); GNW[45 * 128 + (c - 128)] = (bf16)f2bf(-x45); GNW[46 * 128 + (c - 128)] = (bf16)f2bf(-x46); GNW[47 * 128 + (c - 128)] = (bf16)f2bf(-x47); GNW[48 * 128 + (c - 128)] = (bf16)f2bf(-x48); GNW[49 * 128 + (c - 128)] = (bf16)f2bf(-x49); GNW[50 * 128 + (c - 128)] = (bf16)f2bf(-x50); GNW[51 * 128 + (c - 128)] = (bf16)f2bf(-x51); GNW[52 * 128 + (c - 128)] = (bf16)f2bf(-x52); GNW[53 * 128 + (c - 128)] = (bf16)f2bf(-x53); GNW[54 * 128 + (c - 128)] = (bf16)f2bf(-x54); GNW[55 * 128 + (c - 128)] = (bf16)f2bf(-x55); GNW[56 * 128 + (c - 128)] = (bf16)f2bf(-x56); GNW[57 * 128 + (c - 128)] = (bf16)f2bf(-x57); GNW[58 * 128 + (c - 128)] = (bf16)f2bf(-x58); GNW[59 * 128 + (c - 128)] = (bf16)f2bf(-x59); GNW[60 * 128 + (c - 128)] = (bf16)f2bf(-x60); GNW[61 * 128 + (c - 128)] = (bf16)f2bf(-x61); GNW[62 * 128 + (c - 128)] = (bf16)f2bf(-x62); GNW[63 * 128 + (c - 128)] = (bf16)f2bf(-x63); }
#undef GDN_RHS
#undef GDN_L4
    } else {
        const int t2 = tid - 256; const float gl = gcs[63];
        { const int i = t2 >> 2, d0 = (t2 & 3) * 32; const float e = __expf(gcs[i]);
#pragma unroll
          for (int x8 = 0; x8 < 4; ++x8) { const v4f a = *(const LAS v4f*)(qs + i * QP + d0 + 8 * x8), b = *(const LAS v4f*)(qs + i * QP + d0 + 8 * x8 + 4);
              v4u w; w.x = pk2(a.x * e, a.y * e); w.y = pk2(a.z * e, a.w * e); w.z = pk2(b.x * e, b.y * e); w.w = pk2(b.z * e, b.w * e); *(v4u*)(GQG + i * 128 + d0 + 8 * x8) = w; } }
        { const int d = t2 >> 1, j0 = (t2 & 1) * 32;
#pragma unroll
          for (int x8 = 0; x8 < 4; ++x8) { float o[8];
#pragma unroll
              for (int x = 0; x < 8; ++x) { const int j = j0 + 8 * x8 + x; o[x] = ks[j * QP + d] * __expf(gl - gcs[j]); }
              v4u w; w.x = pk2(o[0], o[1]); w.y = pk2(o[2], o[3]); w.z = pk2(o[4], o[5]); w.w = pk2(o[6], o[7]); *(v4u*)(GKT + d * 64 + j0 + 8 * x8) = w; } }
        if (t2 == 0) GDL[item] = __expf(gl);
    }
    __syncthreads();
}
struct GdnFrags { bf16x8_t nw[4], qg[4], at[2], kt[2][2]; float u[4]; float dl; };
__device__ __forceinline__ void gdn_load(GdnFrags& F, const Params& p, int item, int off128, int off64, int offk, int offu) {
    const bf16* GNW = (const bf16*)(p.ws + WS_GNW) + (size_t)item * 8192; const bf16* GQG = (const bf16*)(p.ws + WS_GQG) + (size_t)item * 8192;
    const bf16* GAT = (const bf16*)(p.ws + WS_GAT) + (size_t)item * 4096; const bf16* GKT = (const bf16*)(p.ws + WS_GKT) + (size_t)item * 8192; const float* GU = (const float*)(p.ws + WS_GU) + (size_t)item * 8192;
#pragma unroll
    for (int ks = 0; ks < 4; ++ks) { F.nw[ks] = *(const bf16x8_t*)(GNW + off128 + 32 * ks); F.qg[ks] = *(const bf16x8_t*)(GQG + off128 + 32 * ks); }
#pragma unroll
    for (int ks = 0; ks < 2; ++ks) { F.at[ks] = *(const bf16x8_t*)(GAT + off64 + 32 * ks); F.kt[0][ks] = *(const bf16x8_t*)(GKT + offk + 32 * ks); F.kt[1][ks] = *(const bf16x8_t*)(GKT + offk + 1024 + 32 * ks); }
#pragma unroll
    for (int r = 0; r < 4; ++r) F.u[r] = GU[offu + r * 128];
    F.dl = ((const float*)(p.ws + WS_GDL))[item];
}
constexpr int STP = 136, VNP = 72;
__device__ __forceinline__ void gdn_seq(const Params& p, LAS unsigned char* lds, int wgi, int wave, int lane) {
    const int u = wgi * 2 + (wave >> 2), wi = wave & 3, h = u >> 3, sl = u & 7, g = lane >> 4, c = lane & 15;
    LAS unsigned short* ST = (LAS unsigned short*)(lds + (wave >> 2) * 12288);
    LAS unsigned short* VNT = ST + 2 * 16 * STP;
    float* GO = (float*)(p.ws + WS_GO);
    const int off128 = (16 * wi + c) * 128 + 8 * g, off64 = (16 * wi + c) * 64 + 8 * g, offk = (32 * wi + c) * 64 + 8 * g, offu = (16 * wi + 4 * g) * 128 + 16 * sl + c;
#pragma unroll
    for (int mt = 0; mt < 2; ++mt) *(LAS v2u*)(ST + c * STP + 16 * (2 * wi + mt) + 4 * g) = (v2u){0u, 0u};
    pg8::f32x4 Sacc[2] = {{0.f, 0.f, 0.f, 0.f}, {0.f, 0.f, 0.f, 0.f}};
    __syncthreads();
    GdnFrags F0, F1;
    gdn_load(F0, p, h, off128, off64, offk, offu);
#define GDN_STEP(F, n_) do { const int cur = (n_) & 1; bf16x8_t sf[4]; \
        _Pragma("unroll") for (int ks = 0; ks < 4; ++ks) sf[ks] = *(const LAS bf16x8_t*)(ST + cur * 16 * STP + c * STP + 32 * ks + 8 * g); \
        pg8::f32x4 vn = {F.u[0], F.u[1], F.u[2], F.u[3]}; \
        _Pragma("unroll") for (int ks = 0; ks < 4; ++ks) vn = __builtin_amdgcn_mfma_f32_16x16x32_bf16(F.nw[ks], sf[ks], vn, 0, 0, 0); \
        { v2u w; w.x = pk2(vn[0], vn[1]); w.y = pk2(vn[2], vn[3]); *(LAS v2u*)(VNT + c * VNP + 16 * wi + 4 * g) = w; } \
        LDS_BAR(); \
        const bf16x8_t v0 = *(const LAS bf16x8_t*)(VNT + c * VNP + 8 * g), v1 = *(const LAS bf16x8_t*)(VNT + c * VNP + 32 + 8 * g); \
        pg8::f32x4 o = {0.f, 0.f, 0.f, 0.f}; \
        _Pragma("unroll") for (int ks = 0; ks < 4; ++ks) o = __builtin_amdgcn_mfma_f32_16x16x32_bf16(F.qg[ks], sf[ks], o, 0, 0, 0); \
        o = __builtin_amdgcn_mfma_f32_16x16x32_bf16(F.at[0], v0, o, 0, 0, 0); o = __builtin_amdgcn_mfma_f32_16x16x32_bf16(F.at[1], v1, o, 0, 0, 0); \
        { const size_t tb = (size_t)(n_) * 64 + 16 * wi + 4 * g; _Pragma("unroll") for (int r = 0; r < 4; ++r) GO[(tb + r) * BW + h * 128 + 16 * sl + c] = o[r]; } \
        _Pragma("unroll") for (int mt = 0; mt < 2; ++mt) { Sacc[mt] = Sacc[mt] * F.dl; \
            Sacc[mt] = __builtin_amdgcn_mfma_f32_16x16x32_bf16(F.kt[mt][0], v0, Sacc[mt], 0, 0, 0); Sacc[mt] = __builtin_amdgcn_mfma_f32_16x16x32_bf16(F.kt[mt][1], v1, Sacc[mt], 0, 0, 0); \
            v2u w; w.x = pk2(Sacc[mt][0], Sacc[mt][1]); w.y = pk2(Sacc[mt][2], Sacc[mt][3]); *(LAS v2u*)(ST + (cur ^ 1) * 16 * STP + c * STP + 16 * (2 * wi + mt) + 4 * g) = w; } \
        LDS_BAR(); } while (0)
    for (int n = 0; n < T / 64; n += 2) {
        gdn_load(F1, p, (n + 1) * 4 + h, off128, off64, offk, offu);
        GDN_STEP(F0, n);
        gdn_load(F0, p, ((n + 2 < T / 64) ? n + 2 : n) * 4 + h, off128, off64, offk, offu);
        GDN_STEP(F1, n + 1);
    }
#undef GDN_STEP
}

constexpr int SEQ_UOFF = 132096;
constexpr int GI_NW = 0, GI_QG = 8704, GI_AT = 17408, GI_KT = 22016, GI_SZ = 31232;
struct GdnStage { v4u r[7]; float u[4]; float dl; };
__device__ __forceinline__ void gdn_stage_load(GdnStage& Sg, const Params& p, int item, int tid, int offu) {
    const bf16* GNW = (const bf16*)(p.ws + WS_GNW) + (size_t)item * 8192; const bf16* GQG = (const bf16*)(p.ws + WS_GQG) + (size_t)item * 8192;
    const bf16* GAT = (const bf16*)(p.ws + WS_GAT) + (size_t)item * 4096; const bf16* GKT = (const bf16*)(p.ws + WS_GKT) + (size_t)item * 8192; const float* GU = (const float*)(p.ws + WS_GU) + (size_t)item * 8192;
    Sg.r[0] = *(const v4u*)(GNW + 8 * tid); Sg.r[1] = *(const v4u*)(GNW + 8 * (tid + 512)); Sg.r[2] = *(const v4u*)(GQG + 8 * tid); Sg.r[3] = *(const v4u*)(GQG + 8 * (tid + 512));
    Sg.r[4] = *(const v4u*)(GAT + 8 * tid); Sg.r[5] = *(const v4u*)(GKT + 8 * tid); Sg.r[6] = *(const v4u*)(GKT + 8 * (tid + 512));
#pragma unroll
    for (int r = 0; r < 4; ++r) Sg.u[r] = GU[offu + r * 128];
    Sg.dl = ((const float*)(p.ws + WS_GDL))[item];
}
__device__ __forceinline__ void gdn_stage_write(const GdnStage& Sg, LAS unsigned short* img, int tid) {
    { const int p0 = tid, p1 = tid + 512;
      *(LAS v4u*)(img + GI_NW + (p0 >> 4) * 136 + 8 * (p0 & 15)) = Sg.r[0]; *(LAS v4u*)(img + GI_NW + (p1 >> 4) * 136 + 8 * (p1 & 15)) = Sg.r[1];
      *(LAS v4u*)(img + GI_QG + (p0 >> 4) * 136 + 8 * (p0 & 15)) = Sg.r[2]; *(LAS v4u*)(img + GI_QG + (p1 >> 4) * 136 + 8 * (p1 & 15)) = Sg.r[3];
      *(LAS v4u*)(img + GI_AT + (p0 >> 3) * 72 + 8 * (p0 & 7)) = Sg.r[4];
      *(LAS v4u*)(img + GI_KT + (p0 >> 3) * 72 + 8 * (p0 & 7)) = Sg.r[5]; *(LAS v4u*)(img + GI_KT + (p1 >> 3) * 72 + 8 * (p1 & 7)) = Sg.r[6]; }
}
__device__ __forceinline__ void gdn_seq2(const Params& p, LAS unsigned char* lds, int wgi, int tid, int wave, int lane) {
    const int h = wgi >> 2, sl = 2 * (wgi & 3) + (wave >> 2), wi = wave & 3, g = lane >> 4, c = lane & 15;
    LAS unsigned short* IMG = (LAS unsigned short*)lds;
    LAS unsigned short* ST = (LAS unsigned short*)(lds + SEQ_UOFF + (wave >> 2) * 12288);
    LAS unsigned short* VNT = ST + 2 * 16 * STP;
    float* GO = (float*)(p.ws + WS_GO);
    const int offu = (16 * wi + 4 * g) * 128 + 16 * sl + c;
#pragma unroll
    for (int mt = 0; mt < 2; ++mt) *(LAS v2u*)(ST + c * STP + 16 * (2 * wi + mt) + 4 * g) = (v2u){0u, 0u};
    pg8::f32x4 Sacc[2] = {{0.f, 0.f, 0.f, 0.f}, {0.f, 0.f, 0.f, 0.f}};
    GdnStage A, B;
    gdn_stage_load(A, p, h, tid, offu); gdn_stage_write(A, IMG, tid);
    gdn_stage_load(B, p, 4 + h, tid, offu);
    LDS_BAR();
    constexpr int NCH = T / 64;
#define GDN_STEP2(X, Y, n_) do { const int cur = (n_) & 1; const LAS unsigned short* im = IMG + cur * GI_SZ; bf16x8_t sf[4]; \
        _Pragma("unroll") for (int ks = 0; ks < 4; ++ks) sf[ks] = *(const LAS bf16x8_t*)(ST + cur * 16 * STP + c * STP + 32 * ks + 8 * g); \
        pg8::f32x4 vn = {X.u[0], X.u[1], X.u[2], X.u[3]}; const float dl = X.dl; \
        _Pragma("unroll") for (int ks = 0; ks < 4; ++ks) vn = __builtin_amdgcn_mfma_f32_16x16x32_bf16(*(const LAS bf16x8_t*)(im + GI_NW + (16 * wi + c) * 136 + 32 * ks + 8 * g), sf[ks], vn, 0, 0, 0); \
        { v2u w; w.x = pk2(vn[0], vn[1]); w.y = pk2(vn[2], vn[3]); *(LAS v2u*)(VNT + c * VNP + 16 * wi + 4 * g) = w; } \
        pg8::f32x4 o = {0.f, 0.f, 0.f, 0.f}; \
        _Pragma("unroll") for (int ks = 0; ks < 4; ++ks) o = __builtin_amdgcn_mfma_f32_16x16x32_bf16(*(const LAS bf16x8_t*)(im + GI_QG + (16 * wi + c) * 136 + 32 * ks + 8 * g), sf[ks], o, 0, 0, 0); \
        LDS_BAR(); \
        gdn_stage_load(X, p, (((n_) + 2 < NCH) ? (n_) + 2 : (n_)) * 4 + h, tid, offu); \
        const bf16x8_t v0 = *(const LAS bf16x8_t*)(VNT + c * VNP + 8 * g), v1 = *(const LAS bf16x8_t*)(VNT + c * VNP + 32 + 8 * g); \
        o = __builtin_amdgcn_mfma_f32_16x16x32_bf16(*(const LAS bf16x8_t*)(im + GI_AT + (16 * wi + c) * 72 + 8 * g), v0, o, 0, 0, 0); \
        o = __builtin_amdgcn_mfma_f32_16x16x32_bf16(*(const LAS bf16x8_t*)(im + GI_AT + (16 * wi + c) * 72 + 32 + 8 * g), v1, o, 0, 0, 0); \
        { const size_t tb = (size_t)(n_) * 64 + 16 * wi + 4 * g; _Pragma("unroll") for (int r = 0; r < 4; ++r) GO[(tb + r) * BW + h * 128 + 16 * sl + c] = o[r]; } \
        _Pragma("unroll") for (int mt = 0; mt < 2; ++mt) { Sacc[mt] = Sacc[mt] * dl; \
            Sacc[mt] = __builtin_amdgcn_mfma_f32_16x16x32_bf16(*(const LAS bf16x8_t*)(im + GI_KT + (16 * (2 * wi + mt) + c) * 72 + 8 * g), v0, Sacc[mt], 0, 0, 0); \
            Sacc[mt] = __builtin_amdgcn_mfma_f32_16x16x32_bf16(*(const LAS bf16x8_t*)(im + GI_KT + (16 * (2 * wi + mt) + c) * 72 + 32 + 8 * g), v1, Sacc[mt], 0, 0, 0); \
            v2u w; w.x = pk2(Sacc[mt][0], Sacc[mt][1]); w.y = pk2(Sacc[mt][2], Sacc[mt][3]); *(LAS v2u*)(ST + (cur ^ 1) * 16 * STP + c * STP + 16 * (2 * wi + mt) + 4 * g) = w; } \
        gdn_stage_write(Y, IMG + (cur ^ 1) * GI_SZ, tid); \
        LDS_BAR(); } while (0)
    for (int n = 0; n < NCH; n += 2) { GDN_STEP2(A, B, n); GDN_STEP2(B, A, n + 1); }
#undef GDN_STEP2
}
constexpr int MI_Q = 0, MI_S = 4608, MI_K = 9216, MI_SZ = 13824;
struct MlStage { v4u r[3]; bf16x8_t vt[2]; float fl; };
__device__ __forceinline__ void ml_stage_load(MlStage& Sg, const Params& p, int item, int tid, int offV) {
    const bf16* MQ = (const bf16*)(p.ws + WS_MQ) + (size_t)item * 4096; const bf16* MS = (const bf16*)(p.ws + WS_MS) + (size_t)item * 4096; const bf16* MK = (const bf16*)(p.ws + WS_MK) + (size_t)item * 4096;
    const bf16* MV = (const bf16*)(p.ws + WS_MV) + (size_t)item * 9216;
    Sg.r[0] = *(const v4u*)(MQ + 8 * tid); Sg.r[1] = *(const v4u*)(MS + 8 * tid); Sg.r[2] = *(const v4u*)(MK + 8 * tid);
    Sg.vt[0] = *(const bf16x8_t*)(MV + offV); Sg.vt[1] = *(const bf16x8_t*)(MV + offV + 32);
    Sg.fl = ((const float*)(p.ws + WS_MFL))[item];
}
__device__ __forceinline__ void ml_stage_write(const MlStage& Sg, LAS unsigned short* img, int tid) {
    const int o = (tid >> 3) * 72 + 8 * (tid & 7);
    *(LAS v4u*)(img + MI_Q + o) = Sg.r[0]; *(LAS v4u*)(img + MI_S + o) = Sg.r[1]; *(LAS v4u*)(img + MI_K + o) = Sg.r[2];
}
__device__ __forceinline__ void ml_seq2(const Params& p, LAS unsigned char* lds, int wgi, int tid, int wave, int lane) {
    const int h = wgi / 5, sl0 = 2 * (wgi % 5) + (wave >> 2), wi = wave & 3, g = lane >> 4, c = lane & 15;
    const bool real = sl0 < 9; const int sl = real ? sl0 : 8;
    LAS unsigned short* IMG = (LAS unsigned short*)lds;
    LAS unsigned short* CT = (LAS unsigned short*)(lds + SEQ_UOFF + (wave >> 2) * 8192);
    float* HO = (float*)(p.ws + WS_HO); float* HDEN = (float*)(p.ws + WS_HDEN);
    const int offV = (16 * sl + c) * 64 + 8 * g;
    *(LAS v2u*)(CT + c * 72 + 16 * wi + 4 * g) = (v2u){0u, 0u};
    pg8::f32x4 Cacc = {0.f, 0.f, 0.f, 0.f};
    MlStage A, B;
    ml_stage_load(A, p, h, tid, offV); ml_stage_write(A, IMG, tid);
    ml_stage_load(B, p, 4 + h, tid, offV);
    LDS_BAR();
    constexpr int NCH = T / 64;
#define ML_STEP2(X, Y, n_) do { const int cur = (n_) & 1; const LAS unsigned short* im = IMG + cur * MI_SZ; const int ro = (16 * wi + c) * 72 + 8 * g; \
        const bf16x8_t c0 = *(const LAS bf16x8_t*)(CT + cur * 16 * 72 + c * 72 + 8 * g), c1 = *(const LAS bf16x8_t*)(CT + cur * 16 * 72 + c * 72 + 32 + 8 * g); \
        const bf16x8_t vt0 = X.vt[0], vt1 = X.vt[1]; const float fl = X.fl; \
        pg8::f32x4 num = {0.f, 0.f, 0.f, 0.f}; \
        num = __builtin_amdgcn_mfma_f32_16x16x32_bf16(*(const LAS bf16x8_t*)(im + MI_Q + ro), c0, num, 0, 0, 0); num = __builtin_amdgcn_mfma_f32_16x16x32_bf16(*(const LAS bf16x8_t*)(im + MI_Q + ro + 32), c1, num, 0, 0, 0); \
        num = __builtin_amdgcn_mfma_f32_16x16x32_bf16(*(const LAS bf16x8_t*)(im + MI_S + ro), vt0, num, 0, 0, 0); num = __builtin_amdgcn_mfma_f32_16x16x32_bf16(*(const LAS bf16x8_t*)(im + MI_S + ro + 32), vt1, num, 0, 0, 0); \
        Cacc = Cacc * fl; \
        Cacc = __builtin_amdgcn_mfma_f32_16x16x32_bf16(*(const LAS bf16x8_t*)(im + MI_K + ro), vt0, Cacc, 0, 0, 0); Cacc = __builtin_amdgcn_mfma_f32_16x16x32_bf16(*(const LAS bf16x8_t*)(im + MI_K + ro + 32), vt1, Cacc, 0, 0, 0); \
        ml_stage_load(X, p, (((n_) + 2 < NCH) ? (n_) + 2 : (n_)) * 4 + h, tid, offV); \
        { v2u w; w.x = pk2(Cacc[0], Cacc[1]); w.y = pk2(Cacc[2], Cacc[3]); *(LAS v2u*)(CT + (cur ^ 1) * 16 * 72 + c * 72 + 16 * wi + 4 * g) = w; } \
        { const size_t tb = (size_t)(n_) * 64 + 16 * wi + 4 * g; \
          if (sl < 8) { _Pragma("unroll") for (int r = 0; r < 4; ++r) HO[(tb + r) * BW + h * 128 + 16 * sl + c] = num[r]; } \
          else if (c == 0 && real) { _Pragma("unroll") for (int r = 0; r < 4; ++r) HDEN[(tb + r) * 4 + h] = num[r]; } } \
        ml_stage_write(Y, IMG + (cur ^ 1) * MI_SZ, tid); \
        LDS_BAR(); } while (0)
    for (int n = 0; n < NCH; n += 2) { ML_STEP2(A, B, n); ML_STEP2(B, A, n + 1); }
#undef ML_STEP2
}

__device__ __forceinline__ void mixer_gmlp_item(const Params& p, int l, LAS unsigned char* lds, int item, int tid, int wave, int lane) {
    const int chunk = item >> 2, g = item & 3; const size_t tok0 = (size_t)chunk * 128;
    const bf16* Z = (const bf16*)(p.ws + WS_Z);
    const float* ng = p.in[I_GMNG] + l * BW; const float* nb = p.in[I_GMNB] + l * BW;
    const float* wsp = p.in[I_GMWS] + ((size_t)(l * 4 + g) * 128) * 128; const float* bsp = p.in[I_GMBS] + (l * 4 + g) * 128;
    LAS unsigned short* vT = (LAS unsigned short*)lds;
    {   v4u raw[16];
#pragma unroll
        for (int r = 0; r < 16; ++r) raw[r] = *(const v4u*)(Z + (tok0 + wave * 16 + r) * ZC + ZC_GMV + 8 * lane);
        float gn[8], gb[8];
#pragma unroll
        for (int i = 0; i < 8; ++i) { gn[i] = ng[8 * lane + i]; gb[i] = nb[8 * lane + i]; }
#pragma unroll
        for (int r = 0; r < 16; ++r) { const int tk = wave * 16 + r; float x[8]; unpack8(raw[r], x); float s = 0.f;
#pragma unroll
            for (int i = 0; i < 8; ++i) { x[i] = gelu_tanh(x[i]); s += x[i]; }
            const float mean = wave_sum(s) * (1.f / 512.f); float ss = 0.f;
#pragma unroll
            for (int i = 0; i < 8; ++i) { x[i] -= mean; ss += x[i] * x[i]; }
            const float rstd = rsqrtf(wave_sum(ss) * (1.f / 512.f) + LN_EPS);
            if ((lane >> 4) == g) { const int cl = 8 * (lane & 15);
#pragma unroll
                for (int i = 0; i < 8; ++i) vT[(cl + i) * 136 + tk] = (unsigned short)f2bf(x[i] * rstd * gn[i] + gb[i]); } } }
    __syncthreads();
    {   const int c16 = lane & 15, g4 = lane >> 4, t = 16 * wave + c16, nks = ((16 * wave + 15) >> 5) + 1;
        bf16x8_t wf[4];
#pragma unroll
        for (int ks = 0; ks < 4; ++ks) { wf[ks] = (bf16x8_t){0, 0, 0, 0, 0, 0, 0, 0};
            if (ks < nks) { const float* wp = wsp + (size_t)t * 128 + 32 * ks + 8 * g4; const v4f a = *(const v4f*)wp, b = *(const v4f*)(wp + 4); const int s0 = 32 * ks + 8 * g4;
                const v4u w = (v4u){pk2(s0 <= t ? a.x : 0.f, s0 + 1 <= t ? a.y : 0.f), pk2(s0 + 2 <= t ? a.z : 0.f, s0 + 3 <= t ? a.w : 0.f), pk2(s0 + 4 <= t ? b.x : 0.f, s0 + 5 <= t ? b.y : 0.f), pk2(s0 + 6 <= t ? b.z : 0.f, s0 + 7 <= t ? b.w : 0.f)};
                wf[ks] = __builtin_bit_cast(bf16x8_t, w); } }
        pg8::f32x4 acc[8];
#pragma unroll
        for (int ct = 0; ct < 8; ++ct) acc[ct] = (pg8::f32x4){0.f, 0.f, 0.f, 0.f};
#pragma unroll
        for (int ks = 0; ks < 4; ++ks) { if (ks < nks) {
#pragma unroll
            for (int ct = 0; ct < 8; ++ct) acc[ct] = __builtin_amdgcn_mfma_f32_16x16x32_bf16(*(const LAS bf16x8_t*)(vT + (16 * ct + c16) * 136 + 32 * ks + 8 * g4), wf[ks], acc[ct], 0, 0, 0); } }
        const float bias = bsp[t]; v2u ur[8];
#pragma unroll
        for (int ct = 0; ct < 8; ++ct) ur[ct] = *(const v2u*)(Z + (tok0 + t) * ZC + ZC_GMU + g * 128 + 16 * ct + 4 * g4);
#pragma unroll
        for (int ct = 0; ct < 8; ++ct) { const float u0 = bflo(ur[ct].x), u1 = bfhi(ur[ct].x), u2 = bflo(ur[ct].y), u3 = bfhi(ur[ct].y);
            const float o0 = gelu_tanh(u0) * (acc[ct][0] + bias), o1 = gelu_tanh(u1) * (acc[ct][1] + bias), o2 = gelu_tanh(u2) * (acc[ct][2] + bias), o3 = gelu_tanh(u3) * (acc[ct][3] + bias);
#if MERGE_FP8
            *(unsigned*)((unsigned char*)(p.ws + WS_BR) + (tok0 + t) * BRW + 1 * BW + g * 128 + 16 * ct + 4 * g4) = pk4_f8(o0, o1, o2, o3, BRSC); }
#else
            *(v2u*)((bf16*)(p.ws + WS_BR) + (tok0 + t) * BRW + 1 * BW + g * 128 + 16 * ct + 4 * g4) = (v2u){pk2(o0, o1), pk2(o2, o3)}; }
#endif
    }
    __syncthreads();
}

__device__ __forceinline__ void vt_item(const Params& p, LAS unsigned char* lds, int item, int tid) {
    const int h = item & 3, n = item >> 2; const size_t t0 = (size_t)n * 64;
    const bf16* Z = (const bf16*)(p.ws + WS_Z); bf16* VT = (bf16*)(p.ws + WS_VT);
    LAS unsigned short* vs = (LAS unsigned short*)lds;
#pragma unroll
    for (int r = 0; r < 2; ++r) { const int idx = tid + 512 * r, tk = idx >> 4, c8 = idx & 15;
        *(LAS v4u*)(vs + tk * 136 + 8 * c8) = *(const v4u*)(Z + (t0 + tk) * ZC + ZC_SBV + h * 128 + 8 * c8); }
    __syncthreads();
    { const int d = tid >> 2, jq = tid & 3; unsigned w[8];
#pragma unroll
      for (int x = 0; x < 8; ++x) w[x] = (unsigned)vs[(16 * jq + 2 * x) * 136 + d] | ((unsigned)vs[(16 * jq + 2 * x + 1) * 136 + d] << 16);
      bf16* dst = VT + ((size_t)h * 128 + d) * T + t0 + 16 * jq;
      *(v4u*)dst = (v4u){w[0], w[1], w[2], w[3]}; *(v4u*)(dst + 8) = (v4u){w[4], w[5], w[6], w[7]}; }
    __syncthreads();
}
constexpr int KTP = 136, VTP = 72;
__device__ __forceinline__ void sb_unit(const Params& p, LAS unsigned char* lds, int unit, int tid, int wave, int lane) {
    const int h = unit >> 6, q0 = (unit & 63) * 128, g = lane >> 4, c = lane & 15; const int qrow = q0 + 16 * wave + c;
    const bf16* Z = (const bf16*)(p.ws + WS_Z); const bf16* VT = (const bf16*)(p.ws + WS_VT) + (size_t)h * 128 * T; bf16* BR0 = (bf16*)(p.ws + WS_BR);
    LAS unsigned short* Kt = (LAS unsigned short*)lds;
    LAS unsigned short* Vt = Kt + 2 * 64 * KTP;
    LAS int* flags = (LAS int*)(Vt + 2 * 128 * VTP);
    bf16x8_t qf[4];
#pragma unroll
    for (int ks = 0; ks < 4; ++ks) qf[ks] = *(const bf16x8_t*)(Z + (size_t)qrow * ZC + ZC_SBQ + h * 128 + 32 * ks + 8 * g);
    pg8::f32x4 acc[8];
#pragma unroll
    for (int dt = 0; dt < 8; ++dt) acc[dt] = (pg8::f32x4){0.f, 0.f, 0.f, 0.f};
    float racc = 0.f;
    v4u kr[2], vr[2];
    const int jt = (q0 >> 6) + 1;
#define SB_GLOAD(j_) do { _Pragma("unroll") for (int r = 0; r < 2; ++r) { const int idx = tid + 512 * r; \
        kr[r] = *(const v4u*)(Z + (size_t)(64 * (j_) + (idx >> 4)) * ZC + ZC_SBK + h * 128 + 8 * (idx & 15)); \
        vr[r] = *(const v4u*)(VT + (size_t)(idx >> 3) * T + 64 * (j_) + 8 * (idx & 7)); } } while (0)
#define SB_LWRITE(b_) do { _Pragma("unroll") for (int r = 0; r < 2; ++r) { const int idx = tid + 512 * r; \
        *(LAS v4u*)(Kt + (b_) * 64 * KTP + (idx >> 4) * KTP + 8 * (idx & 15)) = kr[r]; *(LAS v4u*)(Vt + (b_) * 128 * VTP + (idx >> 3) * VTP + 8 * (idx & 7)) = vr[r]; } } while (0)
    LDS_BAR();
    SB_GLOAD(jt); SB_LWRITE(0);
    LDS_BAR();
    for (int j = jt, it = 0; j >= 0; --j, ++it) {
        const int cur = it & 1;
        SB_GLOAD(j > 0 ? j - 1 : 0);
        const bool wdone = __all(racc > 104.f);
        if (64 * j < q0 + 16 * wave + 15 && !wdone) {
            const LAS unsigned short* Kc = Kt + cur * 64 * KTP; const LAS unsigned short* Vc = Vt + cur * 128 * VTP;
            pg8::f32x4 z[4];
#pragma unroll
            for (int s = 0; s < 4; ++s) { z[s] = (pg8::f32x4){0.f, 0.f, 0.f, 0.f};
#pragma unroll
                for (int ks = 0; ks < 4; ++ks) z[s] = __builtin_amdgcn_mfma_f32_16x16x32_bf16(*(const LAS bf16x8_t*)(Kc + (16 * s + c) * KTP + 32 * ks + 8 * g), qf[ks], z[s], 0, 0, 0); }
            float sp[4][4], t[4], xs[4]; bool mk[4][4];
#pragma unroll
            for (int s = 0; s < 4; ++s) { t[s] = 0.f;
#pragma unroll
                for (int r = 0; r < 4; ++r) { const int key = 64 * j + 16 * s + 4 * g + r; mk[s][r] = key < qrow; const float zz = z[s][r] * 0.08838834764831845f; z[s][r] = zz;
                    sp[s][r] = mk[s][r] ? softplusf_(zz) : 0.f; t[s] += sp[s][r]; } }
            float grand = 0.f, higher[4];
#pragma unroll
            for (int s = 3; s >= 0; --s) { float x = t[s]; float y = __shfl(x, lane + 16); x += (g < 3) ? y : 0.f; y = __shfl(x, lane + 32); x += (g < 2) ? y : 0.f;
                xs[s] = x - t[s];
                const float tot = __shfl(x, c); higher[s] = grand; grand += tot; }
            bf16x8_t pf[2];
#pragma unroll
            for (int s = 0; s < 4; ++s) { float a[4]; float e = 0.f;
#pragma unroll
                for (int r = 3; r >= 0; --r) { const float la = z[s][r] - sp[s][r] - (racc + higher[s] + xs[s] + e); a[r] = mk[s][r] ? __expf(la) : 0.f; e += sp[s][r]; }
                const unsigned w0 = pk2(a[0], a[1]), w1 = pk2(a[2], a[3]);
                if ((s & 1) == 0) { pf[s >> 1][0] = (short)(w0 & 0xffff); pf[s >> 1][1] = (short)(w0 >> 16); pf[s >> 1][2] = (short)(w1 & 0xffff); pf[s >> 1][3] = (short)(w1 >> 16); }
                else              { pf[s >> 1][4] = (short)(w0 & 0xffff); pf[s >> 1][5] = (short)(w0 >> 16); pf[s >> 1][6] = (short)(w1 & 0xffff); pf[s >> 1][7] = (short)(w1 >> 16); } }
            racc += grand;
#pragma unroll
            for (int dt = 0; dt < 8; ++dt)
#pragma unroll
                for (int k2 = 0; k2 < 2; ++k2) { const v2u lo = *(const LAS v2u*)(Vc + (16 * dt + c) * VTP + 32 * k2 + 4 * g), hi = *(const LAS v2u*)(Vc + (16 * dt + c) * VTP + 32 * k2 + 16 + 4 * g);
                    const v4u vv = (v4u){lo.x, lo.y, hi.x, hi.y};
                    acc[dt] = __builtin_amdgcn_mfma_f32_16x16x32_bf16(__builtin_bit_cast(bf16x8_t, vv), pf[k2], acc[dt], 0, 0, 0); }
        }
        const bool wd2 = __all(racc > 104.f);
        if (lane == 0) flags[cur * 8 + wave] = wd2 ? 1 : 0;
        SB_LWRITE(cur ^ 1);
        LDS_BAR();
        int alld = 1;
#pragma unroll
        for (int w = 0; w < 8; ++w) alld &= flags[cur * 8 + w];
        if (alld) break;
    }
#undef SB_GLOAD
#undef SB_LWRITE
#pragma unroll
#if MERGE_FP8
    for (int dt = 0; dt < 8; ++dt) *(unsigned*)((unsigned char*)BR0 + (size_t)qrow * BRW + h * 128 + 16 * dt + 4 * g) = pk4_f8(acc[dt][0], acc[dt][1], acc[dt][2], acc[dt][3], BRSC);
#else
    for (int dt = 0; dt < 8; ++dt) { v2u w; w.x = pk2(acc[dt][0], acc[dt][1]); w.y = pk2(acc[dt][2], acc[dt][3]); *(v2u*)(BR0 + (size_t)qrow * BRW + h * 128 + 16 * dt + 4 * g) = w; }
#endif
}

struct GateOrder {
    pg8::StaticOrder s; int pn0;
    __device__ __forceinline__ bool next(int i, pg8::Unit& u) const { if (!s.next(i, u)) return false; u.pn += pn0; return true; }
    __device__ __forceinline__ void a_ready(const pg8::Unit&) const {}
    __device__ __forceinline__ void done(const pg8::Unit&) const {}
};
constexpr int GATE_PN0 = ZC_GATE / 256, GATE_WGS = 128;
__device__ __forceinline__ void phase_mixers(const Params& p, int l, LAS unsigned char* lds, int wg, int G, int tid, int wave, int lane, const XcdBarrier& bar) {
#if defined(PROBE_SPLIT)
    if (wg < 16) gdn_seq2(p, lds, wg, tid, wave, lane); else if (wg < 36) ml_seq2(p, lds, wg - 16, tid, wave, lane);
    xcd_barrier(bar);
    const int w2 = wg, G2 = G;
#else
    if (wg < 16) { gdn_seq2(p, lds, wg, tid, wave, lane); return; }
    if (wg < 36) { ml_seq2(p, lds, wg - 16, tid, wave, lane); return; }
    const int w2 = wg - 36, G2 = G - 36;
#endif
    if (GATE_SPLIT && G == 256) {
        if (w2 < GATE_WGS) {
            for (int it = w2; it < 256; it += GATE_WGS) mixer_gmlp_item(p, l, lds, it, tid, wave, lane);
            for (int it = w2; it < 256; it += GATE_WGS) sb_unit(p, lds, it, tid, wave, lane);
            __syncthreads();
            pg8::Gemm g{(const bf16*)(p.ws + WS_XB), (const bf16*)(p.ws + WS_WIN), T, ZC, D / 2, D / 2, D / 2}; GateOrder S; S.s.init(T, ZC - ZC_GATE, GATE_WGS, w2); S.pn0 = GATE_PN0;
            pg8::EpiBf16<0> E{(bf16*)(p.ws + WS_Z), ZC, nullptr, 0, 0, 1.f / 64.f};
            pg8::gemm_phase<pg8::EpiBf16<0>, GateOrder, true, true, true>(lds, g, S, E);
        } else { const int w3 = w2 - GATE_WGS, G3 = G2 - GATE_WGS; __syncthreads();
            phase_convert<1>(p, l, lds, w3 * 8 + wave, G3 * 8, wave, lane); }
        return; }
    for (int it = w2; it < 256; it += G2) mixer_gmlp_item(p, l, lds, it, tid, wave, lane);
    for (int it = w2; it < 256; it += G2) sb_unit(p, lds, it, tid, wave, lane);
#if !defined(PROBE_CONV0)
    __syncthreads();
    {
        constexpr int NIT1 = (NEX * 2 * (D / 64) * (ED / 32)) + (NEX * (ED / 64) * (D / 32));
        const int nheavy = (G2 < 256 && 2 * G2 >= 256) ? 256 - G2 : 0, per_wave = NIT1 / (G2 * 8);
        const int NA = (nheavy > 0 && per_wave > 2 * CONV_SKIP) ? (per_wave - CONV_SKIP) * (G2 * 8) : NIT1;
        phase_convert<1>(p, l, lds, w2 * 8 + wave, G2 * 8, wave, lane, false, 0, NA);
        if (NA < NIT1 && w2 >= nheavy) phase_convert<1>(p, l, lds, (w2 - nheavy) * 8 + wave, (G2 - nheavy) * 8, wave, lane, false, NA, NIT1); }
#endif
}

__device__ __forceinline__ void phase_post(const Params& p, int l, int gw, int NGW, int lane) {
    const bf16* Z = (const bf16*)(p.ws + WS_Z); const float* GO = (const float*)(p.ws + WS_GO); const float* HO = (const float*)(p.ws + WS_HO); const float* HDEN = (const float*)(p.ws + WS_HDEN);
    bf16* BR2 = (bf16*)(p.ws + WS_BR) + 2 * BW; bf16* BR3 = (bf16*)(p.ws + WS_BR) + 3 * BW;
    const float* gng = p.in[I_GDNNG] + l * 128; const float* mng = p.in[I_MLNG] + l * BW;
    for (int t = gw; t < T; t += NGW) {
        {   const v4f a0 = *(const v4f*)(GO + (size_t)t * BW + 8 * lane), a1 = *(const v4f*)(GO + (size_t)t * BW + 8 * lane + 4); float o[8] = {a0.x, a0.y, a0.z, a0.w, a1.x, a1.y, a1.z, a1.w}; float ss = 0.f;
#pragma unroll
            for (int i = 0; i < 8; ++i) ss += o[i] * o[i];
            const float r = rsqrtf(sum16(ss) * (1.f / 128.f) + LN_EPS);
            const v4u graw = *(const v4u*)(Z + (size_t)t * ZC + ZC_GDNG + 8 * lane); float gt[8]; unpack8(graw, gt);
#pragma unroll
            for (int i = 0; i < 8; ++i) o[i] = o[i] * r * gng[(8 * lane + i) & 127] * siluf_(gt[i]);
#if MERGE_FP8
            *(v2u*)((unsigned char*)(p.ws + WS_BR) + (size_t)t * BRW + 2 * BW + 8 * lane) = (v2u){pk4_f8(o[0], o[1], o[2], o[3], BRSC), pk4_f8(o[4], o[5], o[6], o[7], BRSC)}; }
#else
            v4u w; w.x = pk2(o[0], o[1]); w.y = pk2(o[2], o[3]); w.z = pk2(o[4], o[5]); w.w = pk2(o[6], o[7]); *(v4u*)(BR2 + (size_t)t * BRW + 8 * lane) = w; }
#endif
        {   const v4f a0 = *(const v4f*)(HO + (size_t)t * BW + 8 * lane), a1 = *(const v4f*)(HO + (size_t)t * BW + 8 * lane + 4); float o[8] = {a0.x, a0.y, a0.z, a0.w, a1.x, a1.y, a1.z, a1.w}; float ss = 0.f;
            const float dn = __builtin_amdgcn_rcpf(fmaxf(fabsf(HDEN[(size_t)t * 4 + (lane >> 4)]), 1.f));
#pragma unroll
            for (int i = 0; i < 8; ++i) { o[i] *= dn; ss += o[i] * o[i]; }
            const float r = rsqrtf(sum16(ss) * (1.f / 128.f) + LN_EPS);
            const v4u graw = *(const v4u*)(Z + (size_t)t * ZC + ZC_MLO + 8 * lane); float gt[8]; unpack8(graw, gt);
#pragma unroll
            for (int i = 0; i < 8; ++i) o[i] = o[i] * r * mng[8 * lane + i] * sigmoidf_(gt[i]);
#if MERGE_FP8
            *(v2u*)((unsigned char*)(p.ws + WS_BR) + (size_t)t * BRW + 3 * BW + 8 * lane) = (v2u){pk4_f8(o[0], o[1], o[2], o[3], BRSC), pk4_f8(o[4], o[5], o[6], o[7], BRSC)}; }
#else
            v4u w; w.x = pk2(o[0], o[1]); w.y = pk2(o[2], o[3]); w.z = pk2(o[4], o[5]); w.w = pk2(o[6], o[7]); *(v4u*)(BR3 + (size_t)t * BRW + 8 * lane) = w; }
#endif
    }
}

__device__ __forceinline__ void ln_row(const float* yrow, const float* g, const float* b, int lane, v4f (&v)[8]) {
    const v4f* yr = (const v4f*)yrow + lane; float s = 0.f;
#pragma unroll
    for (int j = 0; j < 8; ++j) { v[j] = yr[64 * j]; s += (v[j].x + v[j].y) + (v[j].z + v[j].w); }
    const float mean = wave_sum(s) * (1.f / D); float s2 = 0.f;
#pragma unroll
    for (int j = 0; j < 8; ++j) { v[j] = v[j] - mean; s2 += (v[j].x * v[j].x + v[j].y * v[j].y) + (v[j].z * v[j].z + v[j].w * v[j].w); }
    const float rstd = rsqrtf(wave_sum(s2) * (1.f / D) + LN_EPS);
#pragma unroll
    for (int j = 0; j < 8; ++j) { const v4f gg = ((const v4f*)g)[lane + 64 * j], bb = ((const v4f*)b)[lane + 64 * j]; v[j] = v[j] * rstd * gg + bb; }
}
constexpr int RT_XP = 2052;
constexpr int RT_TAB = 131072 + 1024;
__device__ __forceinline__ void phase_ln1_router(const Params& p, int l, LAS unsigned char* lds, int wg, int G, int wave, int lane, int cnt_shift = 0) {
    const bf16* Y = (const bf16*)(p.ws + WS_Y); bf16* X1 = (bf16*)(p.ws + WS_X1); bf16* X1B = (bf16*)(p.ws + WS_X1B); int* LIST = (int*)(p.ws + WS_LIST); float* WL = (float*)(p.ws + WS_WL); unsigned* SLOT = (unsigned*)(p.ws + WS_SLOT);
    unsigned* cnt = (unsigned*)(p.ws + WS_CTL) + CW_CNT + l * 4096 + cnt_shift;
    const float* g1 = p.in[I_LN1G] + (size_t)l * D; const float* b1 = p.in[I_LN1B] + (size_t)l * D;
    const float* wr = p.in[I_WR] + (size_t)l * D * NE; const float rbias = p.in[I_RB][l * NE + lane];
    LAS float* xt = (LAS float*)lds;
    LAS float* part = (LAS float*)lds;
    LAS unsigned char* selm = lds + RT_TAB; LAS unsigned char* rkm = selm + 4096; LAS float* wtm = (LAS float*)(rkm + 4096); LAS unsigned* basem = (LAS unsigned*)(wtm + 4096);
    const int n_l = lane & 15, kq = lane >> 4;
    int gi = 0;
    for (int tg = wg; tg < T / 16; tg += G, ++gi) {
        {   v4f va[8], vb[8]; const size_t m0 = (size_t)tg * 16 + 2 * wave;
#pragma unroll
            for (int j = 0; j < 8; ++j) { va[j] = ld4(Y, m0 * D + 4 * lane + 256 * j, true); vb[j] = ld4(Y, (m0 + 1) * D + 4 * lane + 256 * j, true); }
            float sa = 0.f, sb = 0.f;
#pragma unroll
            for (int j = 0; j < 8; ++j) { sa += (va[j].x + va[j].y) + (va[j].z + va[j].w); sb += (vb[j].x + vb[j].y) + (vb[j].z + vb[j].w); }
            const float ma = wave_sum(sa) * (1.f / D), mb = wave_sum(sb) * (1.f / D); float qa = 0.f, qb = 0.f;
#pragma unroll
            for (int j = 0; j < 8; ++j) { va[j] = va[j] - ma; vb[j] = vb[j] - mb; qa += (va[j].x * va[j].x + va[j].y * va[j].y) + (va[j].z * va[j].z + va[j].w * va[j].w); qb += (vb[j].x * vb[j].x + vb[j].y * vb[j].y) + (vb[j].z * vb[j].z + vb[j].w * vb[j].w); }
            const float ra = rsqrtf(wave_sum(qa) * (1.f / D) + LN_EPS), rb = rsqrtf(wave_sum(qb) * (1.f / D) + LN_EPS);
#pragma unroll
            for (int j = 0; j < 8; ++j) { const v4f gg = ((const v4f*)g1)[lane + 64 * j], bb = ((const v4f*)b1)[lane + 64 * j]; va[j] = va[j] * ra * gg + bb; vb[j] = vb[j] * rb * gg + bb; }
#pragma unroll
            for (int rr = 0; rr < 2; ++rr) { const size_t m = m0 + rr; v2u* xo = (v2u*)(X1 + m * D) + lane;
#pragma unroll
                for (int j = 0; j < 8; ++j) { const v4f v = rr ? vb[j] : va[j]; xo[64 * j] = (v2u){pk2(v.x, v.y), pk2(v.z, v.w)};
#if MOE_UP_FP8
                    { unsigned w = 0; w = __builtin_amdgcn_cvt_pk_fp8_f32(v.x, v.y, w, false); w = __builtin_amdgcn_cvt_pk_fp8_f32(v.z, v.w, w, true); ((unsigned*)((unsigned char*)X1B + m * D))[lane + 64 * j] = w; }
#else
                    { v2u o; o.x = pk2(v.x, v.y); o.y = pk2(v.z, v.w); ((v2u*)(X1B + m * D))[lane + 64 * j] = o; }
#endif
                    *(LAS v4f*)(xt + (2 * wave + rr) * RT_XP + 4 * lane + 256 * j) = v; } } }
        __syncthreads();
        {   pg8::f32x4 acc[4];
#pragma unroll
            for (int i = 0; i < 4; ++i) acc[i] = (pg8::f32x4){0.f, 0.f, 0.f, 0.f};
            const float* wb = wr + (size_t)(256 * wave + 4 * kq) * NE + 4 * n_l;
            const LAS float* xa = xt + n_l * RT_XP + 256 * wave + 4 * kq;
            v4f bwa[16], bwb[16];
#define RT_LOADW(dst, sb_) do { _Pragma("unroll") for (int q = 0; q < 16; ++q) dst[q] = *(const v4f*)(wb + (size_t)(16 * (4 * (sb_) + (q >> 2)) + (q & 3)) * NE); } while (0)
#define RT_MMA(src, sb_) do { _Pragma("unroll") for (int sg = 0; sg < 4; ++sg) { const v4f a4 = *(const LAS v4f*)(xa + 16 * (4 * (sb_) + sg)); \
                _Pragma("unroll") for (int c = 0; c < 4; ++c) { const v4f b4 = src[sg * 4 + c]; const float a = c == 0 ? a4.x : c == 1 ? a4.y : c == 2 ? a4.z : a4.w; \
                    acc[0] = __builtin_amdgcn_mfma_f32_16x16x4f32(a, b4.x, acc[0], 0, 0, 0); acc[1] = __builtin_amdgcn_mfma_f32_16x16x4f32(a, b4.y, acc[1], 0, 0, 0); \
                    acc[2] = __builtin_amdgcn_mfma_f32_16x16x4f32(a, b4.z, acc[2], 0, 0, 0); acc[3] = __builtin_amdgcn_mfma_f32_16x16x4f32(a, b4.w, acc[3], 0, 0, 0); } } } while (0)
            RT_LOADW(bwa, 0);
#pragma unroll 1
            for (int h = 0; h < 2; ++h) {
                RT_LOADW(bwb, 1); RT_MMA(bwa, 0);
                if (h == 0) RT_LOADW(bwa, 2);
                RT_MMA(bwb, 1);
                wb += (size_t)128 * NE; xa += 128; asm volatile("" : "+v"(wb));
            }
#undef RT_LOADW
#undef RT_MMA
            __syncthreads();
#pragma unroll
            for (int j = 0; j < 4; ++j) *(LAS v4f*)(part + (wave * 16 + 4 * kq + j) * 64 + 4 * n_l) = (v4f){acc[0][j], acc[1][j], acc[2][j], acc[3][j]}; }
        __syncthreads();
#pragma unroll 1
        for (int rr = 0; rr < 2; ++rr) { const int lr = wave + 8 * rr; float logit = 0.f;
#pragma unroll
            for (int w = 0; w < 8; ++w) logit += part[(w * 16 + lr) * 64 + lane];
            const float s = sigmoid_div(logit), biased = s + rbias;
            const float m1 = max8(biased); const float li = (float)(lane & 7);
            const float first = min8(biased == m1 ? li : 8.f);
            const float m2 = max8(li == first ? -INFINITY : biased);
            const float gs = m1 + m2; const int myg = lane >> 3; int grank = 0;
#pragma unroll
            for (int g2 = 0; g2 < 8; ++g2) { const float o = __builtin_bit_cast(float, __builtin_amdgcn_readlane(__builtin_bit_cast(int, gs), g2 * 8)); grank += (o > gs || (o == gs && g2 < myg)) ? 1 : 0; }
            const float masked = grank < 4 ? biased : -INFINITY; int rank = 0;
#pragma unroll 8
            for (int e2 = 0; e2 < 64; ++e2) { const float o = __builtin_bit_cast(float, __builtin_amdgcn_readlane(__builtin_bit_cast(int, masked), e2)); rank += (o > masked || (o == masked && e2 < lane)) ? 1 : 0; }
            const float wsel = rank < 6 ? s : 0.f; const float tot = wave_sum(wsel);
            const int ri = gi * 16 + lr;
            selm[ri * 64 + lane] = (rank < 6) ? 1 : 0; rkm[ri * 64 + lane] = (unsigned char)rank; wtm[ri * 64 + lane] = wsel / tot * 2.5f; }
        __syncthreads();
    }
    const int nrows = gi * 16;
    if (wave == 0) { unsigned n = 0;
        for (int r = 0; r < nrows; ++r) n += selm[r * 64 + lane];
        unsigned base = 0; if (n && !(PROBE_NOATOM && cnt_shift)) base = __hip_atomic_fetch_add(cnt + 64 * lane, n, __ATOMIC_RELAXED, __HIP_MEMORY_SCOPE_AGENT);
        basem[lane] = base; }
    __syncthreads();
    for (int ri = wave; ri < nrows; ri += 8) { unsigned pos = basem[lane];
        for (int r = 0; r < ri; ++r) pos += selm[r * 64 + lane];
        if (selm[ri * 64 + lane]) { const size_t m = (size_t)(wg + (ri >> 4) * G) * 16 + (ri & 15); const int rk = rkm[ri * 64 + lane];
            LIST[lane * T + pos] = (int)m; WL[lane * T + pos] = wtm[ri * 64 + lane]; SLOT[m * 8 + rk] = ((unsigned)lane << 16) | pos; } }
    __syncthreads();
}
__device__ __forceinline__ void phase_combine_ln2(const Params& p, int l, void* dst, bool dbf, int gw, int NGW, int lane) {
    const bf16* X1 = (const bf16*)(p.ws + WS_X1); const bf16* YE = (const bf16*)(p.ws + WS_YEXP); const unsigned* SLOT = (const unsigned*)(p.ws + WS_SLOT);
    const unsigned* cnt = (const unsigned*)(p.ws + WS_CTL) + CW_CNT + l * 4096;
    const float* g2 = p.in[I_LN2G] + (size_t)l * D; const float* b2 = p.in[I_LN2B] + (size_t)l * D;
    const int tiles = ((int)cnt[64 * lane] + 255) >> 8; const float incl = wave_scan_incl((float)tiles);
    const int toff = (int)incl - tiles;
    const int tsh = __builtin_amdgcn_readlane((int)incl, 63);
    for (int m = gw; m < T; m += NGW) {
        v4f v[8];
#pragma unroll
        for (int j = 0; j < 8; ++j) v[j] = ld4(X1, (size_t)m * D + 4 * lane + 256 * j, true) * ALPHA;
#pragma unroll
        for (int k = 0; k < 7; ++k) { size_t row;
            if (k == 0) row = (size_t)tsh * 256 + m;
            else { const unsigned s = __builtin_amdgcn_readfirstlane(SLOT[(size_t)m * 8 + (k - 1)]); const int e = (int)(s >> 16); row = (size_t)__builtin_amdgcn_readlane(toff, e) * 256 + (s & 0xffffu); }
#if YEXP_FP8
            const unsigned* yr = (const unsigned*)((const unsigned char*)YE + row * D) + lane;
#pragma unroll
            for (int j = 0; j < 8; ++j) { const unsigned y = yr[64 * j]; const auto lo = __builtin_amdgcn_cvt_pk_f32_fp8(y, false), hi = __builtin_amdgcn_cvt_pk_f32_fp8(y, true);
                v[j].x += lo[0] * (1.f / YSC); v[j].y += lo[1] * (1.f / YSC); v[j].z += hi[0] * (1.f / YSC); v[j].w += hi[1] * (1.f / YSC); } }
#else
            const v2u* yr = (const v2u*)(YE + row * D) + lane;
#pragma unroll
            for (int j = 0; j < 8; ++j) { const v2u y = yr[64 * j]; v[j].x += bflo(y.x); v[j].y += bfhi(y.x); v[j].z += bflo(y.y); v[j].w += bfhi(y.y); } }
#endif
        float s = 0.f;
#pragma unroll
        for (int j = 0; j < 8; ++j) s += (v[j].x + v[j].y) + (v[j].z + v[j].w);
        const float mean = wave_sum(s) * (1.f / D); float s2 = 0.f;
#pragma unroll
        for (int j = 0; j < 8; ++j) { v[j] = v[j] - mean; s2 += (v[j].x * v[j].x + v[j].y * v[j].y) + (v[j].z * v[j].z + v[j].w * v[j].w); }
        const float rstd = rsqrtf(wave_sum(s2) * (1.f / D) + LN_EPS);
#pragma unroll
        for (int j = 0; j < 8; ++j) { const v4f gg = ((const v4f*)g2)[lane + 64 * j], bb = ((const v4f*)b2)[lane + 64 * j]; const v4f o = v[j] * rstd * gg + bb;
            if (dbf) ((v2u*)((bf16*)dst + (size_t)m * D))[lane + 64 * j] = (v2u){pk2(o.x, o.y), pk2(o.z, o.w)};
            else ((v4f*)((float*)dst + (size_t)m * D))[lane + 64 * j] = o; }
    }
}

constexpr int NPH = 11;
template <class S> struct DupOrder {
    S s; int n;
    __device__ __forceinline__ bool next(int i, Unit& u) const { return s.next(i >= n ? i - n : i, u); }
    __device__ __forceinline__ int row_token(int i, int r) const { return s.row_token(i >= n ? i - n : i, r); }
    __device__ __forceinline__ void a_ready(const Unit& u) const { s.a_ready(u); }
    __device__ __forceinline__ void done(const Unit& u) const { s.done(u); }
};
template <class S> __device__ __forceinline__ int count_units(const S& s) { Unit u; int n = 0; while (n < 64 && s.next(n, u)) ++n; return n; }
#define ORDER_T(k, T) typename std::conditional<PROBE_DUP == (k), DupOrder<T>, T>::type
template <class S> __device__ __forceinline__ DupOrder<S> make_order(const S& s, std::true_type) { DupOrder<S> d{s, count_units(s)}; d.n = count_units(s); return d; }
template <class S> __device__ __forceinline__ S make_order(const S& s, std::false_type) { return s; }
#define MAKE_ORDER(k, s) make_order(s, std::integral_constant<bool, PROBE_DUP == (k)>())
template <int l>
__device__ __forceinline__ void run_layer(const Params& p, LAS unsigned char* lds, const XcdBarrier& bar, int tid, int lane, int wave, int G, int wg, int gw, int NGW) {
    unsigned char* ws = p.ws;
    {
        const void* xin = (l == 0) ? (const void*)p.in[I_X] : (const void*)(ws + WS_XCUR);
        void* xout = (l == NL - 1) ? (void*)p.out : (void*)(ws + WS_XCUR);
#ifndef PROBE_DUP
#define PROBE_DUP (-1)
#endif
#define IS_GEMM_PH(k) ((k) == 1 || (k) == 5 || (k) == 6 || (k) == 8 || (k) == 9)
#define REP(k) _Pragma("nounroll") for (int _r = 0; _r < ((PROBE_DUP == (k) && !IS_GEMM_PH(k)) ? 2 + (p.ph_lo >> 20) : 1); ++_r)
#ifndef PH_MASK
#define PH_MASK 0x7ff
#endif
#define RUN(k) (((PH_MASK >> (k)) & 1) && p.ph_lo <= l * NPH + (k) && l * NPH + (k) < p.ph_hi)
#define SEAM(k) do { if (l * NPH + (k) + 1 < p.ph_hi) xcd_barrier(bar); } while (0)
        if (RUN(0)) { REP(0) { phase_convert<0>(p, l, lds, gw, NGW, wave, lane);
#if defined(PROBE_CONV0)
            phase_convert<1>(p, l, lds, gw, NGW, wave, lane);
#endif
 phase_xprep(p, l, xin, l > 0, lds, gw, NGW, tid, lane); } SEAM(0); }
        if (RUN(1)) { REP(1) { pg8::Gemm g{(const bf16*)(ws + WS_XB), (const bf16*)(ws + WS_WIN), T, ZC, D / 2, D / 2, D / 2}; pg8::StaticOrder S; S.init(T, (GATE_SPLIT && G == 256) ? ZC_GATE : ZC, G, wg);
            pg8::EpiBf16<0> E{(bf16*)(ws + WS_Z), ZC, nullptr, 0, 0, 1.f / 64.f};
            auto S2 = MAKE_ORDER(1, S); pg8::gemm_phase<pg8::EpiBf16<0>, ORDER_T(1, pg8::StaticOrder), true, true, true>(lds, g, S2, E); } SEAM(1); }
        if (RUN(2)) { REP(2) { for (int it = wg; it < 1536; it += G) { if (it < 512) gdn_pre_item(p, l, lds, it, tid, wave, lane); else if (it < 1024) ml_pre_item(p, l, lds, it - 512, tid, wave, lane); else vt_item(p, lds, it - 1024, tid); } } SEAM(2); }
        if (RUN(3)) { REP(3) { phase_mixers(p, l, lds, wg, G, tid, wave, lane, bar); } SEAM(3); }
        if (RUN(4)) { REP(4) { phase_post(p, l, gw, NGW, lane); } SEAM(4); }
        if (RUN(5)) { REP(5) { constexpr int KM = MERGE_FP8 ? BRW / 2 : BRW; pg8::Gemm g{(const bf16*)(ws + WS_BR), (const bf16*)(ws + WS_WBR), T, D, KM, KM, KM}; pg8::StaticOrder S; S.init(T, D, G, wg);
            EpiMergeH E{(const bf16*)(ws + WS_Z), (bf16*)(ws + WS_MSUM)};
            auto S2 = MAKE_ORDER(5, S); pg8::gemm_phase<EpiMergeH, ORDER_T(5, pg8::StaticOrder), true, true, MERGE_FP8 != 0>(lds, g, S2, E); } SEAM(5); }
        if (RUN(6)) { REP(6) { pg8::Gemm g{(const bf16*)(ws + WS_MSUM), (const bf16*)(ws + WS_WOUT), T, D, D / 2, D / 2, D / 2}; pg8::StaticOrder S; S.init(T, D, G, wg);
            EpiResid E{xin, (bf16*)(ws + WS_Y), 1.f / 64.f, l > 0};
            auto S2 = MAKE_ORDER(6, S); pg8::gemm_phase<EpiResid, ORDER_T(6, pg8::StaticOrder), true, true, true>(lds, g, S2, E); } SEAM(6); }
        if (RUN(7)) { REP(7) { phase_ln1_router(p, l, lds, wg, G, wave, lane, (PROBE_DUP == 7 && _r == 0) ? 16384 : 0); } SEAM(7); }
        if (RUN(8)) { REP(8) { const unsigned* cnt = (const unsigned*)(ws + WS_CTL) + CW_CNT + l * 4096; MoeTab M(lds); moe_tables(M, cnt, tid, lane, wave);
            UpOrder S{M, 0}; S.n = up_order_build(M, (const int*)(ws + WS_LIST), (const float*)(ws + WS_WL), wg, G, tid);
            constexpr int KU = MOE_UP_FP8 ? D / 2 : D;
            pg8::Gemm g{(const bf16*)(ws + WS_X1B), (const bf16*)(ws + WS_WUP), T, NEX * 1024, KU, KU, KU};
            EpiGluSparse E{(LAS const float*)M.wt, (bf16*)(ws + WS_HB)};
            auto S2 = MAKE_ORDER(8, S); pg8::gemm_phase_gather<EpiGluSparse, ORDER_T(8, UpOrder), MOE_UP_FP8 != 0>(lds, g, S2, E); } SEAM(8); }
        if (RUN(9)) { REP(9) { const unsigned* cnt = (const unsigned*)(ws + WS_CTL) + CW_CNT + l * 4096; MoeTab M(lds); moe_tables(M, cnt, tid, lane, wave);
            DownOrder S{M, G, wg, 8 * M.t[65]};
            constexpr int KD = MOE_DN_FP8 ? ED / 2 : ED;
            pg8::Gemm g{(const bf16*)(ws + WS_HB), (const bf16*)(ws + WS_WDN), HROWS, NEX * D, KD, KD, KD};
            EpiYexp E{(bf16*)(ws + WS_YEXP)};
            auto S2 = MAKE_ORDER(9, S); pg8::gemm_phase<EpiYexp, ORDER_T(9, DownOrder), true, true, MOE_DN_FP8 != 0>(lds, g, S2, E); } SEAM(9); }
        if (RUN(10)) { REP(10) { phase_combine_ln2(p, l, xout, l != NL - 1, gw, NGW, lane); } SEAM(10); }
#undef RUN
#undef SEAM
    }
}
__global__ void __launch_bounds__(512, 2) fwd_kernel(Params p) {
    extern __shared__ __attribute__((aligned(16))) unsigned char lds_raw[];
    LAS unsigned char* lds = (LAS unsigned char*)lds_raw;
    const int tid = threadIdx.x, lane = tid & 63, wave = __builtin_amdgcn_readfirstlane(tid >> 6);
    const int G = gridDim.x, wg = blockIdx.x, gw = wg * 8 + wave, NGW = G * 8;
    volatile LAS unsigned* MISC = (volatile LAS unsigned*)(lds + MISC_OFF);
    if (tid < 32) MISC[tid] = 0u;
    __syncthreads();
    unsigned* ctl = (unsigned*)(p.ws + WS_CTL);
    const bool multi = (p.ph_hi - p.ph_lo) > 1;
    XcdBarrier bar; bar.bar = ctl + CW_BAR; bar.x = 0; bar.st = nullptr;
    if (multi) bar = xcd_barrier_post(ctl + CW_BAR, MISC + 8);
    run_layer<0>(p, lds, bar, tid, lane, wave, G, wg, gw, NGW);
    run_layer<1>(p, lds, bar, tid, lane, wave, G, wg, gw, NGW);
}

#ifndef MK_MULTI_LAUNCH
#define MK_MULTI_LAUNCH 0
#endif
extern "C" void kernel_launch(void* const* d_in, const int* in_sizes, int n_in, void* d_out, int out_size, void* d_ws, size_t ws_size, hipStream_t stream) {
    static int grid = 0;
    if (grid == 0) {
        if (n_in != 27 || out_size != T * D || ws_size < WS_END) { fprintf(stderr, "kernel_launch: unexpected shapes (n_in %d out %d ws %zu need %zu)\n", n_in, out_size, ws_size, (size_t)WS_END); grid = -1; return; }
        int dev = 0, cus = 0, per_cu = 0;
        if (hipGetDevice(&dev) != hipSuccess || hipDeviceGetAttribute(&cus, hipDeviceAttributeMultiprocessorCount, dev) != hipSuccess) { grid = -1; return; }
        if (hipFuncSetAttribute((const void*)fwd_kernel, hipFuncAttributeMaxDynamicSharedMemorySize, LDS_BYTES) != hipSuccess) { fprintf(stderr, "kernel_launch: hipFuncSetAttribute failed\n"); grid = -1; return; }
        if (hipOccupancyMaxActiveBlocksPerMultiprocessor(&per_cu, (const void*)fwd_kernel, 512, LDS_BYTES) != hipSuccess || per_cu < 1) { fprintf(stderr, "kernel_launch: occupancy query says %d\n", per_cu); }
        (void)hipGetLastError();
        grid = cus;
    }
    if (grid < 0) return;
    (void)hipMemsetAsync((char*)d_ws + WS_CTL, 0, CTL_ZERO_BYTES, stream);
    Params p{};
    for (int i = 0; i < 27; ++i) p.in[i] = (const float*)d_in[i];
    p.out = (float*)d_out; p.ws = (unsigned char*)d_ws;
#if MK_MULTI_LAUNCH
    for (int ph = 0; ph < NL * NPH; ++ph) { p.ph_lo = ph; p.ph_hi = ph + 1; hipLaunchKernelGGL(fwd_kernel, dim3(grid), dim3(512), LDS_BYTES, stream, p); }
#else
    p.ph_lo = 0; p.ph_hi = NL * NPH; hipLaunchKernelGGL(fwd_kernel, dim3(grid), dim3(512), LDS_BYTES, stream, p);
#endif
}
```

```cpp
#include <hip/hip_runtime.h>
#include <cstdio>
#include <cstdint>
#include <type_traits>
namespace pg8 {
#define PG8_LAS __attribute__((address_space(3)))
typedef unsigned short bf16_t;
typedef short bf16x8 __attribute__((ext_vector_type(8)));
typedef float f32x4 __attribute__((ext_vector_type(4)));
typedef unsigned u32x4 __attribute__((ext_vector_type(4)));
constexpr int BM = 256, BK = 64, HALF = 128, HTB = HALF * BK * 2  , STAGE_BYTES = 8 * HTB, NXCD = 8, WGM = 8;

__host__ __device__ __forceinline__ int lds_byte(int r, int c) { const int st = (r >> 4) * 2 + (c >> 5), rr = r & 15, cc = c & 31, ob = rr * 64 + cc * 2; return st * 1024 + (ob ^ (((ob >> 9) & 1) << 5)); }
__host__ __device__ __forceinline__ void stage_rc(int b, int& R, int& C) { const int st = b / 1024, sb = b % 1024, swz = sb ^ (((sb >> 9) & 1) << 5); R = (st >> 1) * 16 + swz / 64; C = (st & 1) * 32 + (swz % 64) / 2; }
__host__ __device__ __forceinline__ int perm32(int rho) { const int n = rho >> 4, i = rho & 15; return 8 * (i >> 2) + 4 * n + (i & 3); }

struct Unit { int pm, pn, aux; };
struct Gemm { const bf16_t* A; const bf16_t* Bt; int M, N, K, lda, ldb; };

struct StaticOrder {
    int nM, nN, nwg, G, c;
    __host__ __device__ void init(int M, int N, int G_, int c_) { nM = M / BM; nN = N / BM; nwg = nM * nN; G = G_; c = c_; }
    __host__ __device__ bool next(int i, Unit& u) const {
        const long L = (long)i * G + c; if (L >= nwg) return false;
        int wgid = (int)L; { const int q = nwg / NXCD, r = nwg % NXCD, xcd = wgid % NXCD, off = wgid / NXCD; wgid = (xcd < r ? xcd * (q + 1) : r * (q + 1) + (xcd - r) * q) + off; }
        const int nig = WGM * nN, gid = wgid / nig, fm = gid * WGM, gsz = (nM - fm) < WGM ? (nM - fm) : WGM;
        u.pm = fm + ((wgid % nig) % gsz); u.pn = (wgid % nig) / gsz; return true;
    }
    __device__ __forceinline__ void a_ready(const Unit&) const {}
    __device__ __forceinline__ void done(const Unit&) const {}
};

__device__ __forceinline__ unsigned cvt_pk_bf16(float lo, float hi) { unsigned r; asm volatile("v_cvt_pk_bf16_f32 %0, %1, %2" : "=v"(r) : "v"(lo), "v"(hi)); return r; }
typedef float f32x2 __attribute__((ext_vector_type(2)));
__device__ __forceinline__ f32x2 gelu_pk(f32x2 v) {
    const f32x2 av = __builtin_elementwise_abs(v), d = av * 0.2316418882f + 1.0f;
    f32x2 t; t.x = __builtin_amdgcn_rcpf(d.x); t.y = __builtin_amdgcn_rcpf(d.y);
    f32x2 q = t * 0.5307027145f + (-0.7265760135f); q = q * t + 0.7107068705f; q = q * t + (-0.142248368f); q = q * t + 0.127414796f; q = q * t;
    const f32x2 s = (v * v) * (-0.72134752044f);
    f32x2 e; e.x = __builtin_amdgcn_exp2f(s.x); e.y = __builtin_amdgcn_exp2f(s.y);
    const f32x2 m = v * (q * e), r = v - m;
    f32x2 o; o.x = v.x < 0.f ? m.x : r.x; o.y = v.y < 0.f ? m.y : r.y; return o;
}

template <int ACT  > struct EpiBf16 {
    static constexpr bool PERM = true, AFTER_DRAIN = false; static constexpr int MID = 0; static_assert(ACT == 0 || ACT == 1, "EpiBf16: ACT is 0 (none) or 1 (gelu_pk)");
    bf16_t* O; int ldc; const float* bias; int split_cols; size_t split_stride; float scale0;
    __device__ __forceinline__ void operator()(const f32x4 (&acc)[2][2][4][2], const Unit& u, int wr, int wc, int fr, int fq) const {
        const int row0 = u.pm * BM + wr * 64 + fr; int colt = u.pn * BM; bf16_t* base = O;
        float sc = scale0; if (split_cols) { const int t = colt / split_cols; base += (size_t)t * split_stride; colt -= t * split_cols; if (t != 0) sc = 1.f; }
        const int col0 = colt + wc * 32 + 8 * fq, bcol0 = u.pn * BM + wc * 32 + 8 * fq;
        f32x4 bv[2][2];
#pragma unroll
        for (int bj = 0; bj < 2; ++bj)
#pragma unroll
            for (int n = 0; n < 2; ++n) bv[bj][n] = bias ? *(const f32x4*)(bias + bcol0 + bj * HALF + 4 * n) : (f32x4){0.f, 0.f, 0.f, 0.f};
#pragma unroll
        for (int ai = 0; ai < 2; ++ai)
#pragma unroll
            for (int m = 0; m < 4; ++m) { bf16_t* rowp = base + (size_t)(row0 + ai * HALF + m * 16) * ldc + col0;
#pragma unroll
                for (int bj = 0; bj < 2; ++bj) { f32x4 v0 = acc[ai][bj][m][0] + bv[bj][0], v1 = acc[ai][bj][m][1] + bv[bj][1];
                    if (ACT == 1) { f32x2 a = gelu_pk((f32x2){v0[0], v0[1]}), b = gelu_pk((f32x2){v0[2], v0[3]}), c = gelu_pk((f32x2){v1[0], v1[1]}), d = gelu_pk((f32x2){v1[2], v1[3]});
                        v0 = (f32x4){a.x, a.y, b.x, b.y}; v1 = (f32x4){c.x, c.y, d.x, d.y}; }
                    v0 = v0 * sc; v1 = v1 * sc; u32x4 w; w.x = cvt_pk_bf16(v0[0], v0[1]); w.y = cvt_pk_bf16(v0[2], v0[3]); w.z = cvt_pk_bf16(v1[0], v1[1]); w.w = cvt_pk_bf16(v1[2], v1[3]);
                    *(u32x4*)(rowp + bj * HALF) = w; } }
    }
};

typedef int i32x8 __attribute__((ext_vector_type(8)));
__device__ __forceinline__ i32x8 cat8(const bf16x8 a, const bf16x8 b) { typedef int i32x4 __attribute__((ext_vector_type(4))); const i32x4 x = __builtin_bit_cast(i32x4, a), y = __builtin_bit_cast(i32x4, b); return (i32x8){x[0], x[1], x[2], x[3], y[0], y[1], y[2], y[3]}; }
__device__ __forceinline__ bf16x8 lo8(const i32x8 v) { typedef int i32x4 __attribute__((ext_vector_type(4))); return __builtin_bit_cast(bf16x8, __builtin_shufflevector(v, v, 0, 1, 2, 3)); }
__device__ __forceinline__ bf16x8 hi8(const i32x8 v) { typedef int i32x4 __attribute__((ext_vector_type(4))); return __builtin_bit_cast(bf16x8, __builtin_shufflevector(v, v, 4, 5, 6, 7)); }
template <class Epi, class Sched, bool ALIGN_EPI = false, bool SP2 = false, bool FP8 = false>
__device__ __forceinline__ void gemm_phase(PG8_LAS unsigned char* lds, const Gemm g, const Sched& S, const Epi& E) {
    const int tid = threadIdx.x, wid = __builtin_amdgcn_readfirstlane(tid >> 6), lane = tid & 63, wr = wid >> 2, wc = wid & 3, fr = lane & 15, fq = lane >> 4;
    const int K = g.K, nt = K / BK;
    unsigned voffA[2], voffB[2];
#pragma unroll
    for (int i = 0; i < 2; ++i) { int R, C; stage_rc(tid * 16 + i * 8192, R, C); const int Rb = Epi::PERM ? ((R & ~31) + perm32(R & 31)) : R;
        voffA[i] = (unsigned)(R * g.lda + C) * 2u; voffB[i] = (unsigned)(Rb * g.ldb + C) * 2u; }
    const size_t kstep = (size_t)(BK * 2);
    const size_t hstepA = (size_t)HALF * g.lda * 2, hstepB = (size_t)HALF * g.ldb * 2;
    const size_t tstepA = 2 * hstepA, tstepB = 2 * hstepB;
    const unsigned ldsw = (unsigned)wid * 1024u;
    const int aoff = lds_byte(wr * 64 + fr, fq * 8), boff = lds_byte(wc * 32 + fr, fq * 8);
#define PG8_SA(b, h) (((b) * 2 + (h)) * HTB)
#define PG8_SB(b, h) ((4 + (b) * 2 + (h)) * HTB)
#define PG8_STAGE(bufoff, gbase, voff) do { _Pragma("unroll") for (int _i = 0; _i < 2; ++_i) \
        __builtin_amdgcn_global_load_lds((const unsigned*)((const char*)(gbase) + (voff)[_i]), (PG8_LAS unsigned*)(lds + (bufoff) + ldsw + _i * 8192), 16, 0, 0); } while (0)
#define PG8_LDA(dst, b, h) do { _Pragma("unroll") for (int m = 0; m < 4; ++m) { if constexpr (FP8) dst##8[m] = cat8(*(const PG8_LAS bf16x8*)(lds + PG8_SA(b, h) + aoff + m * 2048), *(const PG8_LAS bf16x8*)(lds + PG8_SA(b, h) + aoff + m * 2048 + 1024)); \
        else { _Pragma("unroll") for (int k = 0; k < 2; ++k) dst[m][k] = *(const PG8_LAS bf16x8*)(lds + PG8_SA(b, h) + aoff + m * 2048 + k * 1024); } } } while (0)
#define PG8_LDB(dst, b, h) do { _Pragma("unroll") for (int n = 0; n < 2; ++n) { if constexpr (FP8) dst##8[n] = cat8(*(const PG8_LAS bf16x8*)(lds + PG8_SB(b, h) + boff + n * 2048), *(const PG8_LAS bf16x8*)(lds + PG8_SB(b, h) + boff + n * 2048 + 1024)); \
        else { _Pragma("unroll") for (int k = 0; k < 2; ++k) dst[n][k] = *(const PG8_LAS bf16x8*)(lds + PG8_SB(b, h) + boff + n * 2048 + k * 1024); } } } while (0)
#define PG8_MMA(ai, bj, At, Bt) do { __builtin_amdgcn_s_setprio(1); _Pragma("unroll") for (int m = 0; m < 4; ++m) _Pragma("unroll") for (int n = 0; n < 2; ++n) { \
        if constexpr (FP8) asm volatile("v_mfma_scale_f32_16x16x128_f8f6f4 %0, %1, %2, %0, %3, %3 op_sel_hi:[0,0,0]" : "+v"(acc[ai][bj][m][n]) : "v"(Bt##8[n]), "v"(At##8[m]), "v"(fp8_unit_scale)); \
        else { _Pragma("unroll") for (int k = 0; k < 2; ++k) acc[ai][bj][m][n] = __builtin_amdgcn_mfma_f32_16x16x32_bf16(Bt[n][k], At[m][k], acc[ai][bj][m][n], 0, 0, 0); } } __builtin_amdgcn_s_setprio(0); } while (0)
#define PG8_WAIT_V(n) asm volatile("s_waitcnt vmcnt(" #n ")" ::: "memory")
#define PG8_WAIT_L(n) asm volatile("s_waitcnt lgkmcnt(" #n ")" ::: "memory")
#define PG8_BAR __builtin_amdgcn_s_barrier()
#define PG8_SCHED __builtin_amdgcn_sched_barrier(0)
    Unit cur, nxt; int ui = 0;
    if (!S.next(0, cur)) return;
    f32x4 acc[2][2][4][2];
#pragma unroll
    for (int a = 0; a < 2; ++a)
#pragma unroll
        for (int b = 0; b < 2; ++b)
#pragma unroll
            for (int m = 0; m < 4; ++m)
#pragma unroll
                for (int n = 0; n < 2; ++n) acc[a][b][m][n] = (f32x4){0.f, 0.f, 0.f, 0.f};
    int fp8_unit_scale = 0x7F7F7F7F; asm volatile("" : "+v"(fp8_unit_scale));
    bf16x8 At[4][2], B0[2][2], B1[2][2];
    i32x8 At8[4], B08[2], B18[2];
    const char* cA = (const char*)g.A + (size_t)cur.pm * tstepA; const char* cB = (const char*)g.Bt + (size_t)cur.pn * tstepB;
    S.a_ready(cur);
    if constexpr (SP2) {
        PG8_STAGE(PG8_SB(0, 0), cB, voffB); PG8_STAGE(PG8_SB(0, 1), cB + hstepB, voffB); PG8_STAGE(PG8_SA(0, 0), cA, voffA); PG8_STAGE(PG8_SA(0, 1), cA + hstepA, voffA);
        if (wr == 1) PG8_BAR;
        PG8_WAIT_V(2); PG8_BAR;
        PG8_STAGE(PG8_SB(1, 0), cB + kstep, voffB); PG8_STAGE(PG8_SA(1, 0), cA + kstep, voffA); PG8_STAGE(PG8_SB(1, 1), cB + hstepB + kstep, voffB);
        PG8_WAIT_V(6); PG8_BAR;
    } else {
        PG8_STAGE(PG8_SB(0, 0), cB, voffB); PG8_STAGE(PG8_SA(0, 0), cA, voffA); PG8_STAGE(PG8_SB(0, 1), cB + hstepB, voffB); PG8_STAGE(PG8_SA(0, 1), cA + hstepA, voffA);
        if (wr == 1) PG8_BAR;
        PG8_WAIT_V(4); PG8_BAR;
        PG8_STAGE(PG8_SB(1, 0), cB + kstep, voffB); PG8_STAGE(PG8_SA(1, 0), cA + kstep, voffA); PG8_STAGE(PG8_SB(1, 1), cB + hstepB + kstep, voffB);
        PG8_WAIT_V(6); PG8_BAR;
    }
    for (;;) {
        const bool has_next = S.next(ui + 1, nxt);
        const char* nA = has_next ? (const char*)g.A + (size_t)nxt.pm * tstepA : cA; const char* nB = has_next ? (const char*)g.Bt + (size_t)nxt.pn * tstepB : cB;
        for (int t = 0; t < nt; t += 2) {
            const bool last = (t == nt - 2);
            const char* a1 = cA + (size_t)(t + 1) * kstep;
            const char* a2 = last ? nA : cA + (size_t)(t + 2) * kstep; const char* b2 = last ? nB : cB + (size_t)(t + 2) * kstep;
            const char* a3 = a2 + kstep; const char* b3 = b2 + kstep;
            if (last && has_next) S.a_ready(nxt);
            if constexpr (SP2) {
            if constexpr (Epi::MID > 0) { if (t != 0 && (t % Epi::MID) == 0) { PG8_SCHED; if constexpr (FP8) asm volatile("s_nop 7\n\ts_nop 7" ::: "memory"); E.mid(acc, cur, t / Epi::MID, wr, wc, fr, fq); if constexpr (FP8) asm volatile("s_nop 7" ::: "memory"); PG8_SCHED; } }
            PG8_LDB(B0, 0, 0); PG8_LDB(B1, 0, 1); PG8_SCHED; PG8_LDA(At, 0, 0); PG8_STAGE(PG8_SA(1, 1), a1 + hstepA, voffA);
            PG8_WAIT_V(8); PG8_WAIT_L(0); PG8_BAR; PG8_MMA(0, 0, At, B0); PG8_MMA(0, 1, At, B1); PG8_BAR; PG8_SCHED;
            PG8_LDA(At, 0, 1); PG8_STAGE(PG8_SB(0, 0), b2, voffB); PG8_STAGE(PG8_SB(0, 1), b2 + hstepB, voffB); PG8_STAGE(PG8_SA(0, 0), a2, voffA);
            PG8_WAIT_V(8); PG8_WAIT_L(0); PG8_BAR; PG8_MMA(1, 0, At, B0); PG8_MMA(1, 1, At, B1); PG8_BAR; PG8_SCHED;
            PG8_LDB(B0, 1, 0); PG8_LDB(B1, 1, 1); PG8_SCHED; PG8_LDA(At, 1, 0); PG8_STAGE(PG8_SA(0, 1), a2 + hstepA, voffA);
            PG8_WAIT_V(8); PG8_WAIT_L(0); PG8_BAR; PG8_MMA(0, 0, At, B0); PG8_MMA(0, 1, At, B1); PG8_BAR; PG8_SCHED;
            PG8_LDA(At, 1, 1); PG8_STAGE(PG8_SB(1, 0), b3, voffB); PG8_STAGE(PG8_SB(1, 1), b3 + hstepB, voffB); PG8_STAGE(PG8_SA(1, 0), a3, voffA);
            PG8_WAIT_V(8); PG8_WAIT_L(0); PG8_BAR; PG8_MMA(1, 0, At, B0); PG8_MMA(1, 1, At, B1); PG8_BAR; PG8_SCHED;
            } else {
            PG8_LDB(B0, 0, 0); PG8_SCHED; PG8_LDA(At, 0, 0); PG8_STAGE(PG8_SA(1, 1), a1 + hstepA, voffA);
            PG8_WAIT_L(8); PG8_BAR; PG8_WAIT_L(0); PG8_MMA(0, 0, At, B0); PG8_BAR; PG8_SCHED;
            PG8_LDB(B1, 0, 1); PG8_STAGE(PG8_SB(0, 0), b2, voffB);
            PG8_BAR; PG8_WAIT_L(0); PG8_MMA(0, 1, At, B1); PG8_BAR;
            PG8_LDA(At, 0, 1); PG8_STAGE(PG8_SA(0, 0), a2, voffA);
            PG8_BAR; PG8_WAIT_L(0); PG8_MMA(1, 0, At, B0); PG8_BAR; PG8_SCHED;
            PG8_STAGE(PG8_SB(0, 1), b2 + hstepB, voffB);
            PG8_WAIT_V(6); PG8_BAR; PG8_MMA(1, 1, At, B1); PG8_BAR;
            PG8_LDB(B0, 1, 0); PG8_SCHED; PG8_LDA(At, 1, 0); PG8_STAGE(PG8_SA(0, 1), a2 + hstepA, voffA);
            PG8_WAIT_L(8); PG8_BAR; PG8_WAIT_L(0); PG8_MMA(0, 0, At, B0); PG8_BAR; PG8_SCHED;
            PG8_LDB(B1, 1, 1); PG8_STAGE(PG8_SB(1, 0), b3, voffB);
            PG8_BAR; PG8_WAIT_L(0); PG8_MMA(0, 1, At, B1); PG8_BAR;
            PG8_LDA(At, 1, 1); PG8_STAGE(PG8_SA(1, 0), a3, voffA);
            PG8_BAR; PG8_WAIT_L(0); PG8_MMA(1, 0, At, B0); PG8_BAR; PG8_SCHED;
            PG8_STAGE(PG8_SB(1, 1), b3 + hstepB, voffB);
            PG8_WAIT_V(6); PG8_BAR; PG8_MMA(1, 1, At, B1); PG8_BAR;
            }
        }
        if constexpr (ALIGN_EPI) { if (wr == 0) PG8_BAR; }
        if constexpr (FP8) asm volatile("s_nop 7\n\ts_nop 7" ::: "memory");
        if constexpr (!Epi::AFTER_DRAIN) { E(acc, cur, wr, wc, fr, fq); S.done(cur); }
        if (!has_next) break;
#pragma unroll
        for (int a = 0; a < 2; ++a)
#pragma unroll
            for (int b = 0; b < 2; ++b)
#pragma unroll
                for (int m = 0; m < 4; ++m)
#pragma unroll
                    for (int n = 0; n < 2; ++n) acc[a][b][m][n] = (f32x4){0.f, 0.f, 0.f, 0.f};
        cur = nxt; cA = nA; cB = nB; ++ui;
        if constexpr (ALIGN_EPI) { if (wr == 1) PG8_BAR; }
    }
    PG8_WAIT_V(0);
    if constexpr (!ALIGN_EPI) { if (wr == 0) PG8_BAR; }
    PG8_BAR;
    if constexpr (Epi::AFTER_DRAIN) { E.fused(acc, cur, wr, wc, fr, fq, lds, wid, lane); S.done(cur); }
#undef PG8_SA
#undef PG8_SB
#undef PG8_STAGE
#undef PG8_LDA
#undef PG8_LDB
#undef PG8_MMA
#undef PG8_WAIT_V
#undef PG8_WAIT_L
#undef PG8_BAR
#undef PG8_SCHED
}
template <class Epi, class Sched, bool FP8 = false>
__device__ __forceinline__ void gemm_phase_gather(PG8_LAS unsigned char* lds, const Gemm g, const Sched& S, const Epi& E) {
    const int tid = threadIdx.x, wid = __builtin_amdgcn_readfirstlane(tid >> 6), lane = tid & 63, wr = wid >> 2, wc = wid & 3, fr = lane & 15, fq = lane >> 4;
    const int K = g.K, nt = K / BK;
    unsigned voffB[2]; int RA[2], CA[2];
#pragma unroll
    for (int i = 0; i < 2; ++i) { int R, C; stage_rc(tid * 16 + i * 8192, R, C); const int Rb = Epi::PERM ? ((R & ~31) + perm32(R & 31)) : R;
        RA[i] = R; CA[i] = C; voffB[i] = (unsigned)(Rb * g.ldb + C) * 2u; }
    const size_t kstep = (size_t)(BK * 2);
    const size_t hstepB = (size_t)HALF * g.ldb * 2, tstepB = 2 * hstepB;
    const unsigned ldsw = (unsigned)wid * 1024u;
    const int aoff = lds_byte(wr * 64 + fr, fq * 8), boff = lds_byte(wc * 32 + fr, fq * 8);
#define PG8_SA(b, h) (((b) * 2 + (h)) * HTB)
#define PG8_SB(b, h) ((4 + (b) * 2 + (h)) * HTB)
#define PG8_STAGE(bufoff, gbase, voff) do { _Pragma("unroll") for (int _i = 0; _i < 2; ++_i) \
        __builtin_amdgcn_global_load_lds((const unsigned*)((const char*)(gbase) + (voff)[_i]), (PG8_LAS unsigned*)(lds + (bufoff) + ldsw + _i * 8192), 16, 0, 0); } while (0)
#define PG8_LDA(dst, b, h) do { _Pragma("unroll") for (int m = 0; m < 4; ++m) { if constexpr (FP8) dst##8[m] = cat8(*(const PG8_LAS bf16x8*)(lds + PG8_SA(b, h) + aoff + m * 2048), *(const PG8_LAS bf16x8*)(lds + PG8_SA(b, h) + aoff + m * 2048 + 1024)); \
        else { _Pragma("unroll") for (int k = 0; k < 2; ++k) dst[m][k] = *(const PG8_LAS bf16x8*)(lds + PG8_SA(b, h) + aoff + m * 2048 + k * 1024); } } } while (0)
#define PG8_LDB(dst, b, h) do { _Pragma("unroll") for (int n = 0; n < 2; ++n) { if constexpr (FP8) dst##8[n] = cat8(*(const PG8_LAS bf16x8*)(lds + PG8_SB(b, h) + boff + n * 2048), *(const PG8_LAS bf16x8*)(lds + PG8_SB(b, h) + boff + n * 2048 + 1024)); \
        else { _Pragma("unroll") for (int k = 0; k < 2; ++k) dst[n][k] = *(const PG8_LAS bf16x8*)(lds + PG8_SB(b, h) + boff + n * 2048 + k * 1024); } } } while (0)
#define PG8_MMA(ai, bj, At, Bt) do { __builtin_amdgcn_s_setprio(1); _Pragma("unroll") for (int m = 0; m < 4; ++m) _Pragma("unroll") for (int n = 0; n < 2; ++n) { \
        if constexpr (FP8) asm volatile("v_mfma_scale_f32_16x16x128_f8f6f4 %0, %1, %2, %0, %3, %3 op_sel_hi:[0,0,0]" : "+v"(acc[ai][bj][m][n]) : "v"(Bt##8[n]), "v"(At##8[m]), "v"(fp8_unit_scale)); \
        else { _Pragma("unroll") for (int k = 0; k < 2; ++k) acc[ai][bj][m][n] = __builtin_amdgcn_mfma_f32_16x16x32_bf16(Bt[n][k], At[m][k], acc[ai][bj][m][n], 0, 0, 0); } } __builtin_amdgcn_s_setprio(0); } while (0)
#define PG8_WAIT_V(n) asm volatile("s_waitcnt vmcnt(" #n ")" ::: "memory")
#define PG8_WAIT_L(n) asm volatile("s_waitcnt lgkmcnt(" #n ")" ::: "memory")
#define PG8_BAR __builtin_amdgcn_s_barrier()
#define PG8_SCHED __builtin_amdgcn_sched_barrier(0)
#define PG8_ROWS(dst, ui_) do { _Pragma("unroll") for (int _h = 0; _h < 2; ++_h) _Pragma("unroll") for (int _i = 0; _i < 2; ++_i) \
        dst[_h][_i] = (unsigned)S.row_token((ui_), _h * HALF + RA[_i]) * (unsigned)(g.lda * 2) + (unsigned)(CA[_i] * 2); } while (0)
    Unit cur, nxt; int ui = 0;
    if (!S.next(0, cur)) return;
    f32x4 acc[2][2][4][2];
#pragma unroll
    for (int a = 0; a < 2; ++a)
#pragma unroll
        for (int b = 0; b < 2; ++b)
#pragma unroll
            for (int m = 0; m < 4; ++m)
#pragma unroll
                for (int n = 0; n < 2; ++n) acc[a][b][m][n] = (f32x4){0.f, 0.f, 0.f, 0.f};
    int fp8_unit_scale = 0x7F7F7F7F; asm volatile("" : "+v"(fp8_unit_scale));
    bf16x8 At[4][2], B0[2][2], B1[2][2];
    i32x8 At8[4], B08[2], B18[2];
    unsigned offC[2][2];
    PG8_ROWS(offC, 0);
    const char* gA = (const char*)g.A;
    const char* cB = (const char*)g.Bt + (size_t)cur.pn * tstepB;
    PG8_STAGE(PG8_SB(0, 0), cB, voffB); PG8_STAGE(PG8_SB(0, 1), cB + hstepB, voffB); PG8_STAGE(PG8_SA(0, 0), gA, offC[0]); PG8_STAGE(PG8_SA(0, 1), gA, offC[1]);
    if (wr == 1) PG8_BAR;
    PG8_WAIT_V(2); PG8_BAR;
    PG8_STAGE(PG8_SB(1, 0), cB + kstep, voffB); PG8_STAGE(PG8_SA(1, 0), gA + kstep, offC[0]); PG8_STAGE(PG8_SB(1, 1), cB + hstepB + kstep, voffB);
    PG8_WAIT_V(6); PG8_BAR;
    for (;;) {
        const bool has_next = S.next(ui + 1, nxt);
        const char* nB = has_next ? (const char*)g.Bt + (size_t)nxt.pn * tstepB : cB;
        for (int t = 0; t < nt; t += 2) {
            const bool last = (t == nt - 2);
            const char* a1 = gA + (size_t)(t + 1) * kstep;
            const char* a2 = last ? gA : gA + (size_t)(t + 2) * kstep; const char* b2 = last ? nB : cB + (size_t)(t + 2) * kstep;
            const char* a3 = a2 + kstep; const char* b3 = b2 + kstep;
            PG8_LDB(B0, 0, 0); PG8_LDB(B1, 0, 1); PG8_SCHED; PG8_LDA(At, 0, 0); PG8_STAGE(PG8_SA(1, 1), a1, offC[1]);
            if (last && has_next) { PG8_ROWS(offC, ui + 1); }
            PG8_WAIT_V(8); PG8_WAIT_L(0); PG8_BAR; PG8_MMA(0, 0, At, B0); PG8_MMA(0, 1, At, B1); PG8_BAR; PG8_SCHED;
            PG8_LDA(At, 0, 1); PG8_STAGE(PG8_SB(0, 0), b2, voffB); PG8_STAGE(PG8_SB(0, 1), b2 + hstepB, voffB); PG8_STAGE(PG8_SA(0, 0), a2, offC[0]);
            PG8_WAIT_V(8); PG8_WAIT_L(0); PG8_BAR; PG8_MMA(1, 0, At, B0); PG8_MMA(1, 1, At, B1); PG8_BAR; PG8_SCHED;
            PG8_LDB(B0, 1, 0); PG8_LDB(B1, 1, 1); PG8_SCHED; PG8_LDA(At, 1, 0); PG8_STAGE(PG8_SA(0, 1), a2, offC[1]);
            PG8_WAIT_V(8); PG8_WAIT_L(0); PG8_BAR; PG8_MMA(0, 0, At, B0); PG8_MMA(0, 1, At, B1); PG8_BAR; PG8_SCHED;
            PG8_LDA(At, 1, 1); PG8_STAGE(PG8_SB(1, 0), b3, voffB); PG8_STAGE(PG8_SB(1, 1), b3 + hstepB, voffB); PG8_STAGE(PG8_SA(1, 0), a3, offC[0]);
            PG8_WAIT_V(8); PG8_WAIT_L(0); PG8_BAR; PG8_MMA(1, 0, At, B0); PG8_MMA(1, 1, At, B1); PG8_BAR; PG8_SCHED;
        }
        if (wr == 0) PG8_BAR;
        if constexpr (FP8) asm volatile("s_nop 7\n\ts_nop 7" ::: "memory");
        E(acc, cur, wr, wc, fr, fq); S.done(cur);
        if (!has_next) break;
#pragma unroll
        for (int a = 0; a < 2; ++a)
#pragma unroll
            for (int b = 0; b < 2; ++b)
#pragma unroll
                for (int m = 0; m < 4; ++m)
#pragma unroll
                    for (int n = 0; n < 2; ++n) acc[a][b][m][n] = (f32x4){0.f, 0.f, 0.f, 0.f};
        cur = nxt; cB = nB; ++ui;
        if (wr == 1) PG8_BAR;
    }
    PG8_WAIT_V(0);
    PG8_BAR;
#undef PG8_ROWS
#undef PG8_SA
#undef PG8_SB
#undef PG8_STAGE
#undef PG8_LDA
#undef PG8_LDB
#undef PG8_MMA
#undef PG8_WAIT_V
#undef PG8_WAIT_L
#undef PG8_BAR
#undef PG8_SCHED
}
}

#ifndef GATE_FP8
#define GATE_FP8 1
#endif
#ifndef GATE_SPLIT
#define GATE_SPLIT 1
#endif
#ifndef YEXP_FP8
#define YEXP_FP8 1
#endif
#ifndef CONV_SKIP
#define CONV_SKIP 6
#endif
#ifndef MERGE_FP8
#define MERGE_FP8 1
#endif
#ifndef MOE_DN_FP8
#define MOE_DN_FP8 1
#endif
#ifndef MOE_UP_FP8
#define MOE_UP_FP8 1
#endif
#ifndef PROBE_NOATOM
#define PROBE_NOATOM 0
#endif
constexpr int T = 8192, D = 2048, NL = 2, BW = 512, ZC = 14336, INC = 14352;
constexpr int NE = 64, NEX = 65  , ED = 512;
constexpr int BRW = 4 * BW;
constexpr int HK = NEX * ED;
constexpr float ALPHA = 1.41421356237f;
constexpr float LN_EPS = 1e-5f;
constexpr float UPSC = MOE_UP_FP8 ? (1.f / 64.f) : 1.f;
constexpr float BRSC = MERGE_FP8 ? 8.f : 1.f, MGSC = MERGE_FP8 ? (1.f / (8.f * 64.f)) : 1.f;
constexpr float GSC = 8.f;
constexpr float YSC = 64.f;
constexpr float HSC = 8.f, DNSC = MOE_DN_FP8 ? (1.f / (HSC * 64.f)) : 1.f;
constexpr int ZC_SBQ = 0, ZC_SBK = 512, ZC_SBV = 1024, ZC_GMU = 1536, ZC_GMV = 2048, ZC_GDN = 2560, ZC_GDNG = 4096,
              ZC_MLQ = 4608, ZC_MLK = 4864, ZC_MLV = 5120, ZC_MLO = 5632, ZC_GATE = 6144;

#define GAS __attribute__((address_space(1)))
#define LAS __attribute__((address_space(3)))
typedef unsigned short bf16;
typedef unsigned v4u __attribute__((ext_vector_type(4)));
typedef unsigned v2u __attribute__((ext_vector_type(2)));
typedef float v4f __attribute__((ext_vector_type(4)));
typedef float v2f __attribute__((ext_vector_type(2)));
#define LDS_WAIT() asm volatile("s_waitcnt lgkmcnt(0)" ::: "memory")
#define LDS_BAR() do { asm volatile("s_waitcnt lgkmcnt(0)" ::: "memory"); __builtin_amdgcn_s_barrier(); asm volatile("" ::: "memory"); } while (0)

constexpr size_t MiB = 1u << 20;
constexpr size_t WS_CTL = 0, CTL_ZERO_BYTES = 1 * MiB;
constexpr size_t WS_WIN = 2 * MiB, WS_WBR = 58 * MiB, WS_WOUT = 66 * MiB, WS_WUP = 74 * MiB, WS_WDN = 334 * MiB;
constexpr size_t WS_XB = 464 * MiB, WS_SMALL = 496 * MiB, WS_EG = 497 * MiB, WS_BETA = WS_EG + 256 * 1024, WS_COMB = 498 * MiB;
constexpr size_t WS_Z = 500 * MiB, WS_GQ = 724 * MiB, WS_GK = 740 * MiB, WS_GV = 756 * MiB, WS_GO = 772 * MiB, WS_HO = 788 * MiB;
constexpr size_t WS_BR = 804 * MiB, WS_MTMP = 836 * MiB, WS_MSUM = 900 * MiB, WS_Y = 932 * MiB, WS_X1 = 996 * MiB, WS_X1B = 1060 * MiB;
constexpr size_t WS_XCUR = 1092 * MiB, WS_HB = 1156 * MiB, WS_YEXP = 1236 * MiB, WS_LIST = 1524 * MiB, WS_WL = 1526 * MiB, WS_SLOT = 1528 * MiB, WS_MQ = 1530 * MiB, WS_MS = 1534 * MiB, WS_MK = 1538 * MiB, WS_MV = 1542 * MiB, WS_MFL = 1552 * MiB, WS_HDEN = WS_MFL + 65536, WS_VT = 1553 * MiB, WS_END = 1561 * MiB;
constexpr size_t WS_GU = WS_GQ, WS_GNW = WS_GK, WS_GQG = WS_GK + 8 * MiB, WS_GKT = WS_GV, WS_GAT = WS_GV + 8 * MiB, WS_GDL = WS_GV + 12 * MiB;
constexpr int HROWS = 73728;
static_assert(WS_HB + (size_t)HROWS * ED * 2 <= WS_YEXP && WS_YEXP + (size_t)HROWS * D * 2 <= WS_LIST, "ws map (moe)");
static_assert(WS_WIN + (size_t)ZC * D * 2 <= WS_WBR && WS_WUP + (size_t)NEX * 1024 * D * 2 <= WS_WDN && WS_WDN + (size_t)D * HK * 2 <= WS_XB, "ws map (weights)");
static_assert(WS_Z + (size_t)T * ZC * 2 <= WS_GQ, "ws map (acts)");
constexpr int CW_BAR = 4096, CW_CNT = 16384;
constexpr int TAB_OFF = 131072 + 1024;
constexpr int LDS_BYTES = 163840, MISC_OFF = 131072 + 320;

__device__ __forceinline__ float bflo(unsigned w) { return __uint_as_float(w << 16); }
__device__ __forceinline__ float bfhi(unsigned w) { return __uint_as_float(w & 0xffff0000u); }
__device__ __forceinline__ unsigned f2bf(float f) { unsigned u = __float_as_uint(f); return (u + 0x7fffu + ((u >> 16) & 1u)) >> 16; }
typedef __bf16 bf16n2 __attribute__((ext_vector_type(2))); typedef float f32n2 __attribute__((ext_vector_type(2)));
__device__ __forceinline__ unsigned pk2(float lo, float hi) { const bf16n2 v = __builtin_convertvector((f32n2){lo, hi}, bf16n2); return __builtin_bit_cast(unsigned, v); }
__device__ __forceinline__ unsigned pk4_f8(float a, float b, float c, float d, float sc) {
    a = __builtin_amdgcn_fmed3f(a * sc, -448.f, 448.f); b = __builtin_amdgcn_fmed3f(b * sc, -448.f, 448.f); c = __builtin_amdgcn_fmed3f(c * sc, -448.f, 448.f); d = __builtin_amdgcn_fmed3f(d * sc, -448.f, 448.f);
    unsigned w = 0; w = __builtin_amdgcn_cvt_pk_fp8_f32(a, b, w, false); w = __builtin_amdgcn_cvt_pk_fp8_f32(c, d, w, true); return w; }
__device__ __forceinline__ v4f ld4(const void* base, size_t idx, bool is_bf16) {
    if (is_bf16) { const v2u r = *(const v2u*)((const unsigned short*)base + idx); return (v4f){bflo(r.x), bfhi(r.x), bflo(r.y), bfhi(r.y)}; }
    return *(const v4f*)((const float*)base + idx); }
template <int CTRL> __device__ __forceinline__ float dpp(float x) { return __builtin_bit_cast(float, __builtin_amdgcn_mov_dpp(__builtin_bit_cast(int, x), CTRL, 0xf, 0xf, true)); }
__device__ __forceinline__ float sum4(float x) { x += dpp<0xB1>(x); x += dpp<0x4E>(x); return x; }
__device__ __forceinline__ float sum8(float x) { x = sum4(x); x += dpp<0x141>(x); return x; }
__device__ __forceinline__ float sum16(float x) { x = sum8(x); x += dpp<0x140>(x); return x; }
__device__ __forceinline__ float wave_sum(float x) { x = sum16(x); x += __shfl_xor(x, 16); x += __shfl_xor(x, 32); return x; }
__device__ __forceinline__ float max8(float x) { x = fmaxf(x, dpp<0xB1>(x)); x = fmaxf(x, dpp<0x4E>(x)); x = fmaxf(x, dpp<0x141>(x)); return x; }
__device__ __forceinline__ float min8(float x) { x = fminf(x, dpp<0xB1>(x)); x = fminf(x, dpp<0x4E>(x)); x = fminf(x, dpp<0x141>(x)); return x; }
__device__ __forceinline__ float wave_scan_incl(float v) {
    v += __builtin_bit_cast(float, __builtin_amdgcn_update_dpp(0, __builtin_bit_cast(int, v), 0x111, 0xf, 0xf, true));
    v += __builtin_bit_cast(float, __builtin_amdgcn_update_dpp(0, __builtin_bit_cast(int, v), 0x112, 0xf, 0xf, true));
    v += __builtin_bit_cast(float, __builtin_amdgcn_update_dpp(0, __builtin_bit_cast(int, v), 0x114, 0xf, 0xf, true));
    v += __builtin_bit_cast(float, __builtin_amdgcn_update_dpp(0, __builtin_bit_cast(int, v), 0x118, 0xf, 0xf, true));
    v += __builtin_bit_cast(float, __builtin_amdgcn_update_dpp(0, __builtin_bit_cast(int, v), 0x142, 0xa, 0xf, false));
    v += __builtin_bit_cast(float, __builtin_amdgcn_update_dpp(0, __builtin_bit_cast(int, v), 0x143, 0xc, 0xf, false));
    return v;
}
__device__ __forceinline__ float sigmoidf_(float x) { return __builtin_amdgcn_rcpf(1.f + __expf(-x)); }
__device__ __forceinline__ float sigmoid_div(float x) { return 1.f / (1.f + __expf(-x)); }
__device__ __forceinline__ float siluf_(float x) { return x * __builtin_amdgcn_rcpf(1.f + __expf(-x)); }
__device__ __forceinline__ float softplusf_(float x) { return fmaxf(x, 0.f) + __logf(1.f + __expf(-fabsf(x))); }
__device__ __forceinline__ float gelu_tanh(float x) { const float y = 0.7978845608f * (x + 0.044715f * x * x * x); const float t = 1.f - 2.f * __builtin_amdgcn_rcpf(__expf(2.f * y) + 1.f); return 0.5f * x * (1.f + t); }
__device__ __forceinline__ void unpack8(const v4u r, float (&f)[8]) { f[0] = bflo(r.x); f[1] = bfhi(r.x); f[2] = bflo(r.y); f[3] = bfhi(r.y); f[4] = bflo(r.z); f[5] = bfhi(r.z); f[6] = bflo(r.w); f[7] = bfhi(r.w); }
#define XB_TMO      128
#define XB_XCNT(j)  (256  + 64 * (j))
#define XB_XSUB(j)  (1280 + 64 * (j))
#define XB_XGEN(j)  (2304 + 64 * (j))
#define XB_TOP      3328
#define XB_TOPGEN   3392
#define XCD_BAR_WORDS 3456
#define XB_SPIN_CAP (1u << 18)

__device__ __forceinline__ unsigned xb_ld(unsigned* p)              { return __hip_atomic_load(p, __ATOMIC_RELAXED, __HIP_MEMORY_SCOPE_AGENT); }
__device__ __forceinline__ unsigned xb_add(unsigned* p, unsigned v) { return __hip_atomic_fetch_add(p, v, __ATOMIC_RELAXED, __HIP_MEMORY_SCOPE_AGENT); }
__device__ __forceinline__ unsigned xb_xcc_id() { return (unsigned)__builtin_amdgcn_s_getreg((3 << 11) | 20) & 0xFu; }
#define XB_SPIN(cond, bar) do { unsigned _sp = 0; while (cond) { __builtin_amdgcn_s_sleep(1); \
    if ((++_sp & 255u) == 0u) { if (xb_ld(&(bar)[XB_TMO])) break; if (_sp > XB_SPIN_CAP) { atomicAdd(&(bar)[XB_TMO], 1u); break; } } } } while (0)

struct XcdBarrier {
    unsigned* bar; unsigned x;
    volatile LAS unsigned* st;
};

__device__ __forceinline__ XcdBarrier xcd_barrier_post(unsigned* bar, volatile LAS unsigned* st) {
    XcdBarrier b; b.bar = bar; b.x = xb_xcc_id(); b.st = st;
    if (threadIdx.x == 0) (void)xb_add(&bar[XB_XCNT(b.x)], 1u);
    return b;
}
__device__ __forceinline__ void xcd_barrier_complete(unsigned* bar, unsigned x, unsigned& nloc, unsigned& nx) {
    const unsigned G = gridDim.x * gridDim.y * gridDim.z;
    unsigned sum, cnt, mine, sp = 0u;
    for (;;) {
        sum = 0u; cnt = 0u; mine = 0u;
#pragma unroll
        for (unsigned j = 0; j < 16; ++j) { const unsigned c = xb_ld(&bar[XB_XCNT(j)]); sum += c; cnt += (c > 0u) ? 1u : 0u; mine = (j == x) ? c : mine; }
        if (sum == G) break;
        __builtin_amdgcn_s_sleep(1);
        if ((++sp & 255u) == 0u) { if (xb_ld(&bar[XB_TMO])) break; if (sp > XB_SPIN_CAP) { atomicAdd(&bar[XB_TMO], 1u); break; } }
    }
    nloc = mine > 0u ? mine : 1u; nx = cnt > 0u ? cnt : 1u;
}

__device__ __forceinline__ void xcd_barrier(const XcdBarrier& b) {
    asm volatile("s_waitcnt vmcnt(0)" ::: "memory");
    __syncthreads();
    if (threadIdx.x == 0) {
        unsigned* bar = b.bar;
        __builtin_amdgcn_s_waitcnt(0);
        unsigned nloc = b.st[0], nx = b.st[1];
        if (nloc == 0u) { xcd_barrier_complete(bar, b.x, nloc, nx); b.st[0] = nloc; b.st[1] = nx; }
        const unsigned old = xb_add(&bar[XB_XSUB(b.x)], 1u);
        const unsigned gen = old / nloc;
        if (old + 1u == (gen + 1u) * nloc) {
            __builtin_amdgcn_fence(__ATOMIC_RELEASE, "agent");
            asm volatile("s_waitcnt vmcnt(0)" ::: "memory");
            const unsigned og = xb_add(&bar[XB_TOP], 1u);
            const unsigned tg = og / nx;
            if (og + 1u == (tg + 1u) * nx) xb_add(&bar[XB_TOPGEN], 1u);
            else XB_SPIN(xb_ld(&bar[XB_TOPGEN]) == tg, bar);
            __builtin_amdgcn_fence(__ATOMIC_ACQUIRE, "agent");
            xb_add(&bar[XB_XGEN(b.x)], 1u);
            asm volatile("s_waitcnt vmcnt(0)" ::: "memory");
        } else {
            XB_SPIN(xb_ld(&bar[XB_XGEN(b.x)]) == gen, bar);
            __builtin_amdgcn_fence(__ATOMIC_ACQUIRE, "agent");
            asm volatile("s_waitcnt vmcnt(0)" ::: "memory");
        }
    }
    __syncthreads();
}

struct Params { const float* in[27]; float* out; unsigned char* ws; int ph_lo, ph_hi; };
enum { I_X = 0, I_WIN, I_GMNG, I_GMNB, I_GMWS, I_GMBS, I_CONVW, I_ALOG, I_DTB, I_GDNNG, I_MLIB, I_MLFB, I_MLNG, I_WBR, I_WOUT, I_LN1G, I_LN1B,
       I_WR, I_RB, I_WG, I_WU, I_WD, I_SG, I_SU, I_SD, I_LN2G, I_LN2B };

using pg8::f32x4; using pg8::u32x4; using pg8::Unit; using pg8::HALF; using pg8::BM;

struct EpiGate8 {
    static constexpr bool PERM = true, AFTER_DRAIN = false; static constexpr int MID = 0;
    unsigned char* ZG; float sc;
    __device__ __forceinline__ void operator()(const f32x4 (&acc)[2][2][4][2], const Unit& u, int wr, int wc, int fr, int fq) const {
        const int row0 = u.pm * BM + wr * 64 + fr, col0 = u.pn * BM - ZC_GATE + wc * 32 + 8 * fq; const float k = sc * GSC;
#pragma unroll
        for (int ai = 0; ai < 2; ++ai)
#pragma unroll
            for (int m = 0; m < 4; ++m)
#pragma unroll
                for (int bj = 0; bj < 2; ++bj) { const f32x4 v0 = acc[ai][bj][m][0], v1 = acc[ai][bj][m][1];
                    *(v2u*)(ZG + (size_t)(row0 + ai * HALF + m * 16) * (4 * D) + col0 + bj * HALF) = (v2u){pk4_f8(v0[0], v0[1], v0[2], v0[3], k), pk4_f8(v1[0], v1[1], v1[2], v1[3], k)}; }
    }
};
struct EpiMergeH {
    static constexpr bool PERM = true, AFTER_DRAIN = false; static constexpr int MID = MERGE_FP8 ? BW / (2 * pg8::BK) : BW / pg8::BK;
    const bf16* Z; bf16* msum;
    __device__ __forceinline__ void mid(f32x4 (&acc)[2][2][4][2], const Unit& u, int j, int wr, int wc, int fr, int fq) const {
        int row0 = u.pm * BM + wr * 64 + fr; const int col0 = u.pn * BM + wc * 32 + 8 * fq; asm volatile("" : "+v"(row0));
#if GATE_FP8
        const unsigned char* zp = (const unsigned char*)Z + (size_t)(j - 1) * D + col0;
#else
        const bf16* zp = Z + ZC_GATE + (size_t)(j - 1) * D + col0;
#endif
#if GATE_FP8
        v2u ga[2][2][2], gb[2][2][2];
#else
        v4u ga[2][2][2], gb[2][2][2];
#endif
#if GATE_FP8
#define MH_LD1(buf, m, bj, ai_, m0_) do { const unsigned char* q = zp + (size_t)(row0 + ai_ * HALF + (m0_ + m) * 16) * (4 * D) + bj * HALF; ga[buf][m][bj] = *(const v2u*)q; gb[buf][m][bj] = *(const v2u*)(q + D); } while (0)
#define MH_UNPK(w, f) do { const auto _l0 = __builtin_amdgcn_cvt_pk_f32_fp8(w.x, false), _h0 = __builtin_amdgcn_cvt_pk_f32_fp8(w.x, true), _l1 = __builtin_amdgcn_cvt_pk_f32_fp8(w.y, false), _h1 = __builtin_amdgcn_cvt_pk_f32_fp8(w.y, true); \
        f[0] = _l0[0] * (1.f / GSC); f[1] = _l0[1] * (1.f / GSC); f[2] = _h0[0] * (1.f / GSC); f[3] = _h0[1] * (1.f / GSC); f[4] = _l1[0] * (1.f / GSC); f[5] = _l1[1] * (1.f / GSC); f[6] = _h1[0] * (1.f / GSC); f[7] = _h1[1] * (1.f / GSC); } while (0)
#else
#define MH_LD1(buf, m, bj, ai_, m0_) do { const bf16* q = zp + (size_t)(row0 + ai_ * HALF + (m0_ + m) * 16) * ZC + bj * HALF; ga[buf][m][bj] = *(const v4u*)q; gb[buf][m][bj] = *(const v4u*)(q + D); } while (0)
#define MH_UNPK(w, f) unpack8(w, f)
#endif
#define MH_LOAD(buf, am_) do { const int ai_ = (am_) >> 1, m0_ = ((am_) & 1) * 2; _Pragma("unroll") for (int m = 0; m < 2; ++m) _Pragma("unroll") for (int bj = 0; bj < 2; ++bj) { \
            MH_LD1(buf, m, bj, ai_, m0_); } } while (0)
#define MH_APPLY(buf, am_) do { const int ai_ = (am_) >> 1, m0_ = ((am_) & 1) * 2; _Pragma("unroll") for (int m = 0; m < 2; ++m) _Pragma("unroll") for (int bj = 0; bj < 2; ++bj) { float a[8], b[8]; MH_UNPK(ga[buf][m][bj], a); MH_UNPK(gb[buf][m][bj], b); \
            _Pragma("unroll") for (int i = 0; i < 8; ++i) { const float ea = __builtin_amdgcn_exp2f(fmaxf(a[i], -60.f) * -1.44269504f), eb = __builtin_amdgcn_exp2f(fmaxf(b[i], -60.f) * -1.44269504f); \
                acc[ai_][bj][m0_ + m][i >> 2][i & 3] *= (1.f + eb) * __builtin_amdgcn_rcpf(1.f + ea); } } } while (0)
        MH_LOAD(0, 0); MH_LOAD(1, 1); asm volatile("" ::: "memory");
        MH_APPLY(0, 0); asm volatile("" ::: "memory"); MH_LOAD(0, 2); asm volatile("" ::: "memory");
        MH_APPLY(1, 1); asm volatile("" ::: "memory"); MH_LOAD(1, 3); asm volatile("" ::: "memory");
        MH_APPLY(0, 2); asm volatile("" ::: "memory");
        MH_APPLY(1, 3); asm volatile("" ::: "memory");
#undef MH_LOAD
#undef MH_APPLY
#undef MH_LD1
    }
    __device__ __forceinline__ void operator()(const f32x4 (&acc)[2][2][4][2], const Unit& u, int wr, int wc, int fr, int fq) const {
        const int row0 = u.pm * BM + wr * 64 + fr, col0 = u.pn * BM + wc * 32 + 8 * fq;
#pragma unroll
#if GATE_FP8
        for (int ai = 0; ai < 2; ++ai) { v2u gg[4][2];
#pragma unroll
            for (int m = 0; m < 4; ++m)
#pragma unroll
                for (int bj = 0; bj < 2; ++bj) gg[m][bj] = *(const v2u*)((const unsigned char*)Z + (size_t)(row0 + ai * HALF + m * 16) * (4 * D) + 3 * D + col0 + bj * HALF);
#else
        for (int ai = 0; ai < 2; ++ai) { v4u gg[4][2];
#pragma unroll
            for (int m = 0; m < 4; ++m)
#pragma unroll
                for (int bj = 0; bj < 2; ++bj) gg[m][bj] = *(const v4u*)(Z + (size_t)(row0 + ai * HALF + m * 16) * ZC + ZC_GATE + 3 * D + col0 + bj * HALF);
#endif
#pragma unroll
            for (int m = 0; m < 4; ++m)
#pragma unroll
                for (int bj = 0; bj < 2; ++bj) { const size_t row = (size_t)(row0 + ai * HALF + m * 16); const int col = col0 + bj * HALF; float gl[8]; MH_UNPK(gg[m][bj], gl);
                    f32x4 v0 = acc[ai][bj][m][0], v1 = acc[ai][bj][m][1];
#pragma unroll
                    for (int j = 0; j < 4; ++j) { v0[j] *= sigmoidf_(gl[j]) * MGSC; v1[j] *= sigmoidf_(gl[4 + j]) * MGSC; }
                    unsigned w0 = 0, w1 = 0; w0 = __builtin_amdgcn_cvt_pk_fp8_f32(v0[0], v0[1], w0, false); w0 = __builtin_amdgcn_cvt_pk_fp8_f32(v0[2], v0[3], w0, true); w1 = __builtin_amdgcn_cvt_pk_fp8_f32(v1[0], v1[1], w1, false); w1 = __builtin_amdgcn_cvt_pk_fp8_f32(v1[2], v1[3], w1, true);
                    *(v2u*)((unsigned char*)msum + row * D + col) = (v2u){w0, w1}; }
            asm volatile("" ::: "memory"); }
    }
};
struct EpiResid {
    static constexpr bool PERM = true, AFTER_DRAIN = false; static constexpr int MID = 0;
    const void* X; bf16* Y; float sc; bool xbf;
    __device__ __forceinline__ void operator()(const f32x4 (&acc)[2][2][4][2], const Unit& u, int wr, int wc, int fr, int fq) const {
        const int row0 = u.pm * BM + wr * 64 + fr, col0 = u.pn * BM + wc * 32 + 8 * fq;
#pragma unroll
        for (int ai = 0; ai < 2; ++ai)
#pragma unroll
            for (int m = 0; m < 4; ++m) { const size_t off = (size_t)(row0 + ai * HALF + m * 16) * D + col0;
#pragma unroll
                for (int bj = 0; bj < 2; ++bj) { const f32x4 x0 = ld4(X, off + bj * HALF, xbf), x1 = ld4(X, off + bj * HALF + 4, xbf);
                    const f32x4 v0 = x0 * ALPHA + acc[ai][bj][m][0] * sc, v1 = x1 * ALPHA + acc[ai][bj][m][1] * sc;
                    u32x4 w; w.x = pk2(v0[0], v0[1]); w.y = pk2(v0[2], v0[3]); w.z = pk2(v1[0], v1[1]); w.w = pk2(v1[2], v1[3]); *(u32x4*)(Y + off + bj * HALF) = w; } }
    }
};
struct MoeTab {
    LAS int* t; LAS unsigned short* tok; LAS float* wt; LAS unsigned char* mte;
    __device__ __forceinline__ MoeTab(LAS unsigned char* lds) : t((LAS int*)(lds + TAB_OFF)), tok((LAS unsigned short*)(lds + TAB_OFF + 1024)), wt((LAS float*)(lds + TAB_OFF + 5120)), mte((LAS unsigned char*)(lds + TAB_OFF + 13312)) {}
};
__device__ __forceinline__ void moe_tables(const MoeTab& M, const unsigned* cnt  , int tid, int lane, int wave) {
    __syncthreads();
    if (wave == 0) { const int c = (int)cnt[64 * lane]; const int tiles = (c + 255) >> 8; const float incl = wave_scan_incl((float)tiles);
        M.t[80 + lane] = c; M.t[lane] = (int)incl - tiles; if (lane == 63) { M.t[64] = (int)incl; M.t[65] = (int)incl + T / 256; M.t[80 + 64] = T; } }
    __syncthreads();
    const int Mt = M.t[65];
    for (int mt = tid; mt < Mt; mt += 512) { int e = 0;
        for (int k = 1; k <= 64; ++k) e = (M.t[k] <= mt) ? k : e;
        M.mte[mt] = (unsigned char)e; }
    __syncthreads();
}
struct UpOrder {
    MoeTab M; int n;
    __device__ __forceinline__ bool next(int i, Unit& u) const { if (i >= n) return false; u.pm = M.t[168 + i]; u.pn = M.t[176 + i]; u.aux = i; return true; }
    __device__ __forceinline__ int row_token(int i, int r) const { return (int)M.tok[i * 256 + r]; }
    __device__ __forceinline__ void a_ready(const Unit&) const {}
    __device__ __forceinline__ void done(const Unit&) const {}
};
__device__ __forceinline__ int up_order_build(const MoeTab& M, const int* LIST, const float* WL, int wg, int G, int tid) {
    const int U = 4 * M.t[65];
    if (tid < 8) { const int L = tid * G + wg; if (L < U) { const int mt = L >> 2, q = L & 3, e = M.mte[mt]; M.t[168 + tid] = mt; M.t[176 + tid] = e * 4 + q; M.t[184 + tid] = e; M.t[192 + tid] = mt - M.t[e]; } }
    int n = 0;
#pragma unroll
    for (int i = 0; i < 8; ++i) n += (i * G + wg < U) ? 1 : 0;
    __syncthreads();
    for (int idx = tid; idx < n * 256; idx += 512) { const int i = idx >> 8, r = idx & 255, e = M.t[184 + i], li = M.t[192 + i] * 256 + r;
        int tk = 0; float w = 0.f;
        if (e < NE) { if (li < M.t[80 + e]) { tk = LIST[e * T + li]; w = WL[e * T + li]; } } else { tk = li; w = 1.f; }
        M.tok[idx] = (unsigned short)tk; M.wt[idx] = w; }
    __syncthreads();
    return n;
}
struct EpiGluSparse {
    static constexpr bool PERM = true, AFTER_DRAIN = false; static constexpr int MID = 0;
    LAS const float* wt; bf16* H;
    __device__ __forceinline__ void operator()(const f32x4 (&acc)[2][2][4][2], const Unit& u, int wr, int wc, int fr, int fq) const {
        const int q = u.pn & 3; const int rl0 = wr * 64 + fr, col0 = q * 128 + wc * 32 + 8 * fq;
#pragma unroll
        for (int ai = 0; ai < 2; ++ai)
#pragma unroll
            for (int m = 0; m < 4; ++m) { const int rl = rl0 + ai * HALF + m * 16; const float c = wt[u.aux * 256 + rl]; float h[8];
#pragma unroll
                for (int n = 0; n < 2; ++n)
#pragma unroll
                    for (int j = 0; j < 4; ++j) h[4 * n + j] = siluf_(acc[ai][0][m][n][j] * UPSC) * (acc[ai][1][m][n][j] * UPSC) * c;
#if MOE_DN_FP8
#pragma unroll
                for (int j = 0; j < 8; ++j) h[j] = __builtin_amdgcn_fmed3f(h[j] * HSC, -448.f, 448.f);
                unsigned w0 = 0, w1 = 0; w0 = __builtin_amdgcn_cvt_pk_fp8_f32(h[0], h[1], w0, false); w0 = __builtin_amdgcn_cvt_pk_fp8_f32(h[2], h[3], w0, true); w1 = __builtin_amdgcn_cvt_pk_fp8_f32(h[4], h[5], w1, false); w1 = __builtin_amdgcn_cvt_pk_fp8_f32(h[6], h[7], w1, true);
                *(v2u*)((unsigned char*)H + ((size_t)u.pm * 256 + rl) * ED + col0) = (v2u){w0, w1}; }
#else
                u32x4 w; w.x = pk2(h[0], h[1]); w.y = pk2(h[2], h[3]); w.z = pk2(h[4], h[5]); w.w = pk2(h[6], h[7]);
                *(u32x4*)(H + ((size_t)u.pm * 256 + rl) * ED + col0) = w; }
#endif
    }
};
struct DownOrder {
    MoeTab M; int G, c, U;
    __device__ __forceinline__ bool next(int i, Unit& u) const { const int L = i * G + c; if (L >= U) return false; const int mt = L >> 3, e = (int)M.mte[mt]; u.pm = mt; u.pn = e * 8 + (L & 7); const int left = M.t[80 + e] - 256 * (mt - M.t[e]); u.aux = left < 256 ? left : 256; return true; }
    __device__ __forceinline__ void a_ready(const Unit&) const {}
    __device__ __forceinline__ void done(const Unit&) const {}
};
struct EpiYexp {
    static constexpr bool PERM = true, AFTER_DRAIN = false; static constexpr int MID = 0;
    bf16* Y;
    __device__ __forceinline__ void operator()(const f32x4 (&acc)[2][2][4][2], const Unit& u, int wr, int wc, int fr, int fq) const {
        const int row0 = u.pm * BM + wr * 64 + fr, col0 = (u.pn & 7) * BM + wc * 32 + 8 * fq;
#pragma unroll
        for (int ai = 0; ai < 2; ++ai)
#pragma unroll
            for (int m = 0; m < 4; ++m) { bf16* rowp = Y + (size_t)(row0 + ai * HALF + m * 16) * D + col0;
                if (wr * 64 + fr + ai * HALF + m * 16 >= u.aux) continue;
#pragma unroll
                for (int bj = 0; bj < 2; ++bj) { const f32x4 v0 = acc[ai][bj][m][0] * DNSC, v1 = acc[ai][bj][m][1] * DNSC;
#if YEXP_FP8
                    *(v2u*)((unsigned char*)Y + (size_t)(row0 + ai * HALF + m * 16) * D + col0 + bj * HALF) = (v2u){pk4_f8(v0[0], v0[1], v0[2], v0[3], YSC), pk4_f8(v1[0], v1[1], v1[2], v1[3], YSC)}; } }
#else
                    u32x4 w; w.x = pk2(v0[0], v0[1]); w.y = pk2(v0[2], v0[3]); w.z = pk2(v1[0], v1[1]); w.w = pk2(v1[2], v1[3]); *(u32x4*)(rowp + bj * HALF) = w; } }
#endif
    }
};

struct TrItem { const float* src; bf16* dst; unsigned sld, dld; int f8; };
__device__ __forceinline__ void tr_load(const TrItem& t, int lane, v4f (&v)[8]) { const int r8 = lane >> 3, c4 = lane & 7;
#pragma unroll
    for (int i = 0; i < 8; ++i) v[i] = *(const v4f*)(t.src + (size_t)(8 * i + r8) * t.sld + 4 * c4); }
__device__ __forceinline__ void tr_store(const TrItem& t, const v4f (&v)[8], LAS float* scr, int lane, bool nostore = false) {
    { const int r8 = lane >> 3, c4 = lane & 7;
#pragma unroll
      for (int i = 0; i < 8; ++i) { LAS float* d = scr + (8 * i + r8) * 33 + 4 * c4; d[0] = v[i].x; d[1] = v[i].y; d[2] = v[i].z; d[3] = v[i].w; } }
    LDS_WAIT(); asm volatile("" ::: "memory");
    if (nostore) return;
    if (t.f8) {
        const int c = lane & 3;
#pragma unroll
        for (int j = 0; j < 2; ++j) { const int n = (lane >> 2) + 16 * j; const LAS float* s = scr + (16 * c) * 33 + n; unsigned w[4];
#pragma unroll
            for (int q = 0; q < 4; ++q) { unsigned x = 0; x = __builtin_amdgcn_cvt_pk_fp8_f32(s[(4 * q) * 33] * 64.f, s[(4 * q + 1) * 33] * 64.f, x, false); x = __builtin_amdgcn_cvt_pk_fp8_f32(s[(4 * q + 2) * 33] * 64.f, s[(4 * q + 3) * 33] * 64.f, x, true); w[q] = x; }
            *(v4u*)((unsigned char*)t.dst + (size_t)n * t.dld + 16 * c) = (v4u){w[0], w[1], w[2], w[3]}; }
    } else {
        const int c = lane & 7;
#pragma unroll
        for (int j = 0; j < 4; ++j) { const int n = (lane >> 3) + 8 * j; const LAS float* s = scr + (8 * c) * 33 + n;
            v4u o; o.x = pk2(s[0 * 33], s[1 * 33]); o.y = pk2(s[2 * 33], s[3 * 33]); o.z = pk2(s[4 * 33], s[5 * 33]); o.w = pk2(s[6 * 33], s[7 * 33]);
            *(v4u*)(t.dst + (size_t)n * t.dld + 8 * c) = o; }
    }
    LDS_WAIT(); asm volatile("" ::: "memory");
}
template <int PART> __device__ __forceinline__ TrItem tr_decode(const Params& p, int l, int it) {
    unsigned char* ws = p.ws;
    constexpr int N_IN = (ZC / 32) * (D / 64), N_BR = 4 * (BW / 64) * (D / 32), N_OUT = (D / 64) * (D / 32), N_UP = NEX * 2 * (D / 64) * (ED / 32);
    int r = it; TrItem t; t.f8 = 0;
    if (PART == 0) {
        const float* w_in = p.in[I_WIN] + (size_t)l * D * INC; const float* w_br = p.in[I_WBR] + (size_t)l * 4 * BW * D; const float* w_out = p.in[I_WOUT] + (size_t)l * D * D;
        bf16* WIN = (bf16*)(ws + WS_WIN); bf16* WBR = (bf16*)(ws + WS_WBR); bf16* WOUT = (bf16*)(ws + WS_WOUT);
        if (r < N_IN) { const int kb = r / (ZC / 32), n0 = (r % (ZC / 32)) * 32, k0 = kb * 64; const int sc = n0 + (n0 >= ZC_GATE ? 16 : (n0 >= ZC_MLQ ? 8 : 0));
            t.src = w_in + (size_t)k0 * INC + sc; t.sld = INC; t.dst = (bf16*)((unsigned char*)WIN + (size_t)n0 * D + k0); t.dld = D; t.f8 = 1; return t; } r -= N_IN;
        if (r < N_BR) { const int g = r / 512, rr = r % 512, k0 = (rr / 64) * 64, n0 = (rr % 64) * 32;
            t.src = w_br + ((size_t)g * BW + k0) * D + n0; t.sld = D;
#if MERGE_FP8
            t.dst = (bf16*)((unsigned char*)WBR + (size_t)n0 * BRW + g * BW + k0); t.dld = BRW; t.f8 = 1; return t; }
#else
            t.dst = WBR + (size_t)n0 * BRW + g * BW + k0; t.dld = BRW; return t; }
#endif
        r -= N_BR;
        { const int k0 = (r / 64) * 64, n0 = (r % 64) * 32; t.src = w_out + (size_t)k0 * D + n0; t.sld = D; t.dst = (bf16*)((unsigned char*)WOUT + (size_t)n0 * D + k0); t.dld = D; t.f8 = 1; return t; }
    } else {
        const float* w_g = p.in[I_WG] + (size_t)l * NE * D * ED; const float* w_u = p.in[I_WU] + (size_t)l * NE * D * ED; const float* w_d = p.in[I_WD] + (size_t)l * NE * ED * D;
        const float* s_g = p.in[I_SG] + (size_t)l * D * ED; const float* s_u = p.in[I_SU] + (size_t)l * D * ED; const float* s_d = p.in[I_SD] + (size_t)l * ED * D;
        bf16* WUP = (bf16*)(ws + WS_WUP); bf16* WDN = (bf16*)(ws + WS_WDN);
        if (r < N_UP) { const int e = r / 1024, rr = r % 1024, mat = rr / 512, r2 = rr % 512, k0 = (r2 / 16) * 64, n0 = (r2 % 16) * 32;
            const float* sb = (e < NE) ? ((mat ? w_u : w_g) + (size_t)e * D * ED) : (mat ? s_u : s_g);
            const int drow = e * 1024 + (n0 / 128) * 256 + mat * 128 + (n0 % 128);
            t.src = sb + (size_t)k0 * ED + n0; t.sld = ED;
#if MOE_UP_FP8
            t.dst = (bf16*)((unsigned char*)WUP + (size_t)drow * D + k0); t.dld = D; t.f8 = 1; return t; }
#else
            t.dst = WUP + (size_t)drow * D + k0; t.dld = D; return t; }
#endif
        r -= N_UP;
        { const int e = r / 512, rr = r % 512, k0 = (rr / 64) * 64, n0 = (rr % 64) * 32;
            const float* sb = (e < NE) ? (w_d + (size_t)e * ED * D) : s_d;
            t.src = sb + (size_t)k0 * D + n0; t.sld = D;
#if MOE_DN_FP8
            t.dst = (bf16*)((unsigned char*)WDN + ((size_t)e * D + n0) * ED + k0); t.dld = ED; t.f8 = 1; return t; }
#else
            t.dst = WDN + ((size_t)e * D + n0) * ED + k0; t.dld = ED; return t; }
#endif
    }
}
template <int PART> __device__ __forceinline__ void phase_convert(const Params& p, int l, LAS unsigned char* lds, int gw, int NGW, int wave, int lane, bool nostore = false, int lo = 0, int hi = 1 << 30) {
    constexpr int N_IN = (ZC / 32) * (D / 64), N_BR = 4 * (BW / 64) * (D / 32), N_OUT = (D / 64) * (D / 32), N_UP = NEX * 2 * (D / 64) * (ED / 32), N_DN = NEX * (ED / 64) * (D / 32);
    constexpr int NITEMS = (PART == 0) ? (N_IN + N_BR + N_OUT) : (N_UP + N_DN);
    LAS float* scr = (LAS float*)(lds + wave * 16384);
    const int NIT = hi < NITEMS ? hi : NITEMS;
    if (lo + gw >= NIT) return;
    TrItem cur = tr_decode<PART>(p, l, lo + gw); v4f va[8], vb[8];
    tr_load(cur, lane, va);
    for (int it = lo + gw; it < NIT; it += 2 * NGW) {
        const int i1 = it + NGW, i2 = it + 2 * NGW; TrItem nx = cur;
        if (i1 < NIT) { nx = tr_decode<PART>(p, l, i1); } tr_load(nx, lane, vb);
        tr_store(cur, va, scr, lane, nostore);
        if (i1 >= NIT) break;
        cur = nx; if (i2 < NIT) { cur = tr_decode<PART>(p, l, i2); } tr_load(cur, lane, va);
        tr_store(nx, vb, scr, lane, nostore);
        if (i2 >= NIT) break;
    }
}
__device__ __forceinline__ void phase_xprep(const Params& p, int l, const void* xin, bool xbf, LAS unsigned char* lds, int gw, int NGW, int tid, int lane) {
    const float* w_in = p.in[I_WIN] + (size_t)l * D * INC;
    constexpr int XP = 2052; LAS float* xt = (LAS float*)lds; LAS float* part = (LAS float*)lds;
    const int wave = tid >> 6, n_l = lane & 15, kq = lane >> 4, wg = gw >> 3, G = NGW >> 3;
    const int colw = n_l < 8 ? 4608 + n_l : 6152 + (n_l - 8);
    float bw[64];
#pragma unroll
    for (int q = 0; q < 64; ++q) bw[q] = w_in[(size_t)(256 * wave + 16 * (q >> 2) + 4 * kq + (q & 3)) * INC + colw];
    unsigned char* XB = p.ws + WS_XB; float* SMALL = (float*)(p.ws + WS_SMALL);
    __syncthreads();
    for (int tg = wg; tg < T / 16; tg += G) {
        {   v4f va[8], vb[8]; const size_t m0 = (size_t)tg * 16 + 2 * wave;
#pragma unroll
            for (int j = 0; j < 8; ++j) { va[j] = ld4(xin, m0 * D + 4 * lane + 256 * j, xbf); vb[j] = ld4(xin, (m0 + 1) * D + 4 * lane + 256 * j, xbf); }
#pragma unroll
            for (int rr = 0; rr < 2; ++rr) { unsigned* xo = (unsigned*)(XB + (m0 + rr) * D) + lane;
#pragma unroll
                for (int j = 0; j < 8; ++j) { const v4f v = rr ? vb[j] : va[j]; unsigned w = 0; w = __builtin_amdgcn_cvt_pk_fp8_f32(v.x, v.y, w, false); w = __builtin_amdgcn_cvt_pk_fp8_f32(v.z, v.w, w, true); xo[64 * j] = w;
                    *(LAS v4f*)(xt + (2 * wave + rr) * XP + 4 * lane + 256 * j) = v; } } }
        __syncthreads();
        {   pg8::f32x4 acc[4];
#pragma unroll
            for (int i = 0; i < 4; ++i) acc[i] = (pg8::f32x4){0.f, 0.f, 0.f, 0.f};
            const LAS float* xa = xt + n_l * XP + 256 * wave + 4 * kq;
#pragma unroll
            for (int s2 = 0; s2 < 16; ++s2) { const v4f a4 = *(const LAS v4f*)(xa + 16 * s2);
                acc[0] = __builtin_amdgcn_mfma_f32_16x16x4f32(a4.x, bw[4 * s2 + 0], acc[0], 0, 0, 0); acc[1] = __builtin_amdgcn_mfma_f32_16x16x4f32(a4.y, bw[4 * s2 + 1], acc[1], 0, 0, 0);
                acc[2] = __builtin_amdgcn_mfma_f32_16x16x4f32(a4.z, bw[4 * s2 + 2], acc[2], 0, 0, 0); acc[3] = __builtin_amdgcn_mfma_f32_16x16x4f32(a4.w, bw[4 * s2 + 3], acc[3], 0, 0, 0); }
            const pg8::f32x4 tot = (acc[0] + acc[1]) + (acc[2] + acc[3]);
            __syncthreads();
#pragma unroll
            for (int j = 0; j < 4; ++j) part[(wave * 16 + 4 * kq + j) * 16 + n_l] = tot[j]; }
        __syncthreads();
        if (tid < 256) { float a = 0.f;
#pragma unroll
            for (int w = 0; w < 8; ++w) a += part[w * 256 + tid];
            SMALL[(size_t)tg * 256 + tid] = a; }
        __syncthreads();
    }
}


typedef short bf16x8_t __attribute__((ext_vector_type(8)));
__device__ __forceinline__ void ml_pre_item(const Params& p, int l, LAS unsigned char* lds, int item, int tid, int wave, int lane) {
    const int h = item & 3, n = item >> 2; const size_t t0 = (size_t)n * 64;
    const bf16* Z = (const bf16*)(p.ws + WS_Z); const float* SMALL = (const float*)(p.ws + WS_SMALL);
    bf16* MQ = (bf16*)(p.ws + WS_MQ) + (size_t)item * 4096; bf16* MS = (bf16*)(p.ws + WS_MS) + (size_t)item * 4096; bf16* MK = (bf16*)(p.ws + WS_MK) + (size_t)item * 4096;
    bf16* MV = (bf16*)(p.ws + WS_MV) + (size_t)item * 9216; float* MFL = (float*)(p.ws + WS_MFL);
    LAS float* qs = (LAS float*)lds;
    LAS float* ks = qs + 64 * 65;
    LAS float* bs = ks + 64 * 65;
    LAS unsigned short* vs = (LAS unsigned short*)(bs + 128);
    { const int tk = tid >> 3, c8 = tid & 7; float f[8];
      unpack8(*(const v4u*)(Z + (t0 + tk) * ZC + ZC_MLQ + h * 64 + 8 * c8), f);
#pragma unroll
      for (int i = 0; i < 8; ++i) qs[tk * 65 + 8 * c8 + i] = f[i];
      unpack8(*(const v4u*)(Z + (t0 + tk) * ZC + ZC_MLK + h * 64 + 8 * c8), f);
#pragma unroll
      for (int i = 0; i < 8; ++i) ks[tk * 65 + 8 * c8 + i] = f[i]; }
#pragma unroll
    for (int r = 0; r < 2; ++r) { const int idx = tid + 512 * r, tk = idx >> 4, c8 = idx & 15;
        *(LAS v4u*)(vs + tk * 136 + 8 * c8) = *(const v4u*)(Z + (t0 + tk) * ZC + ZC_MLV + h * 128 + 8 * c8); }
    if (wave == 0) { const float fp = SMALL[(t0 + lane) * 16 + 12 + h] + p.in[I_MLFB][l * 4 + h]; const float lf = -softplusf_(-fp);
        bs[lane] = wave_scan_incl(lf); bs[64 + lane] = SMALL[(t0 + lane) * 16 + 8 + h] + p.in[I_MLIB][l * 4 + h]; }
    __syncthreads();
    const float blast = bs[63];
    { const int i = tid >> 3, jb = tid & 7; const float bi = bs[i];
      { const float e = __expf(bi) * 0.125f; float o[8];
#pragma unroll
        for (int x = 0; x < 8; ++x) o[x] = qs[i * 65 + 8 * jb + x] * e;
        v4u w; w.x = pk2(o[0], o[1]); w.y = pk2(o[2], o[3]); w.z = pk2(o[4], o[5]); w.w = pk2(o[6], o[7]); *(v4u*)(MQ + i * 64 + 8 * jb) = w; }
      {
          const int ti = wave >> 1, c16 = lane & 15, g4 = lane >> 4, i2 = 16 * ti + c16; const float bi2 = bs[i2];
#define ML_F8(dst, base) do { const LAS float* _b = (base); const v4u _w = (v4u){pg8::cvt_pk_bf16(_b[0], _b[1]), pg8::cvt_pk_bf16(_b[2], _b[3]), pg8::cvt_pk_bf16(_b[4], _b[5]), pg8::cvt_pk_bf16(_b[6], _b[7])}; dst = __builtin_bit_cast(bf16x8_t, _w); } while (0)
          bf16x8_t bq[2];
#pragma unroll
          for (int s2 = 0; s2 < 2; ++s2) ML_F8(bq[s2], qs + i2 * 65 + 32 * s2 + 8 * g4);
#pragma unroll
          for (int jj = 0; jj < 2; ++jj) { const int tj = 2 * (wave & 1) + jj; v2u sw = (v2u){0u, 0u};
              if (tj <= ti) { pg8::f32x4 d = {0.f, 0.f, 0.f, 0.f};
#pragma unroll
                  for (int s2 = 0; s2 < 2; ++s2) { bf16x8_t a; ML_F8(a, ks + (16 * tj + c16) * 65 + 32 * s2 + 8 * g4); d = __builtin_amdgcn_mfma_f32_16x16x32_bf16(a, bq[s2], d, 0, 0, 0); }
                  float v4[4];
#pragma unroll
                  for (int r = 0; r < 4; ++r) { const int j = 16 * tj + 4 * g4 + r; v4[r] = (j <= i2) ? __expf(bi2 - bs[j] + bs[64 + j]) * d[r] * 0.125f : 0.f; }
                  sw = (v2u){pk2(v4[0], v4[1]), pk2(v4[2], v4[3])}; }
              *(v2u*)(MS + i2 * 64 + 16 * tj + 4 * g4) = sw; }
#undef ML_F8
      }
      { float o[8];
#pragma unroll
        for (int x = 0; x < 8; ++x) { const int j = 8 * jb + x; o[x] = ks[j * 65 + i] * __expf(blast - bs[j] + bs[64 + j]); }
        v4u w; w.x = pk2(o[0], o[1]); w.y = pk2(o[2], o[3]); w.z = pk2(o[4], o[5]); w.w = pk2(o[6], o[7]); *(v4u*)(MK + i * 64 + 8 * jb) = w; }
    }
    { const int c = tid >> 2, jq = tid & 3; unsigned w[8];
#pragma unroll
      for (int x = 0; x < 8; ++x) w[x] = (unsigned)vs[(16 * jq + 2 * x) * 136 + c] | ((unsigned)vs[(16 * jq + 2 * x + 1) * 136 + c] << 16);
      *(v4u*)(MV + c * 64 + 16 * jq) = (v4u){w[0], w[1], w[2], w[3]}; *(v4u*)(MV + c * 64 + 16 * jq + 8) = (v4u){w[4], w[5], w[6], w[7]};
      if (tid < 64) { const int c2 = 128 + (tid >> 2); const unsigned one = (c2 == 128) ? 0x3F803F80u : 0u;
          *(v4u*)(MV + c2 * 64 + 16 * jq) = (v4u){one, one, one, one}; *(v4u*)(MV + c2 * 64 + 16 * jq + 8) = (v4u){one, one, one, one}; } }
    if (tid == 0) MFL[item] = __expf(blast);
    __syncthreads();
}
struct MlFrags { bf16x8_t q[2], s[2], kt[2], vt[2]; float fl; };
__device__ __forceinline__ void ml_load(MlFrags& F, const Params& p, int item, int offA, int offV) {
    const bf16* MQ = (const bf16*)(p.ws + WS_MQ) + (size_t)item * 4096; const bf16* MS = (const bf16*)(p.ws + WS_MS) + (size_t)item * 4096; const bf16* MK = (const bf16*)(p.ws + WS_MK) + (size_t)item * 4096;
    const bf16* MV = (const bf16*)(p.ws + WS_MV) + (size_t)item * 9216;
#pragma unroll
    for (int ks = 0; ks < 2; ++ks) { F.q[ks] = *(const bf16x8_t*)(MQ + offA + 32 * ks); F.s[ks] = *(const bf16x8_t*)(MS + offA + 32 * ks); F.kt[ks] = *(const bf16x8_t*)(MK + offA + 32 * ks); F.vt[ks] = *(const bf16x8_t*)(MV + offV + 32 * ks); }
    F.fl = ((const float*)(p.ws + WS_MFL))[item];
}
__device__ __forceinline__ void ml_seq(const Params& p, LAS unsigned char* lds, int wgi, int wave, int lane) {
    const int u = wgi * 2 + (wave >> 2), wi = wave & 3, h = u / 9, sl = u % 9, g = lane >> 4, c = lane & 15;
    LAS unsigned short* CT = (LAS unsigned short*)(lds + (wave >> 2) * 4096);
    float* HO = (float*)(p.ws + WS_HO); float* HDEN = (float*)(p.ws + WS_HDEN);
    const int offA = (16 * wi + c) * 64 + 8 * g, offV = (16 * sl + c) * 64 + 8 * g;
    *(LAS v2u*)(CT + c * 64 + 16 * wi + 4 * g) = (v2u){0u, 0u};
    pg8::f32x4 Cacc = {0.f, 0.f, 0.f, 0.f};
    __syncthreads();
    MlFrags F0, F1;
    ml_load(F0, p, h, offA, offV);
#define ML_STEP(F, n_) do { const int cur = (n_) & 1; \
        const bf16x8_t c0 = *(const LAS bf16x8_t*)(CT + cur * 1024 + c * 64 + 8 * g), c1 = *(const LAS bf16x8_t*)(CT + cur * 1024 + c * 64 + 32 + 8 * g); \
        pg8::f32x4 num = {0.f, 0.f, 0.f, 0.f}; \
        num = __builtin_amdgcn_mfma_f32_16x16x32_bf16(F.q[0], c0, num, 0, 0, 0); num = __builtin_amdgcn_mfma_f32_16x16x32_bf16(F.q[1], c1, num, 0, 0, 0); \
        num = __builtin_amdgcn_mfma_f32_16x16x32_bf16(F.s[0], F.vt[0], num, 0, 0, 0); num = __builtin_amdgcn_mfma_f32_16x16x32_bf16(F.s[1], F.vt[1], num, 0, 0, 0); \
        Cacc = Cacc * F.fl; \
        Cacc = __builtin_amdgcn_mfma_f32_16x16x32_bf16(F.kt[0], F.vt[0], Cacc, 0, 0, 0); Cacc = __builtin_amdgcn_mfma_f32_16x16x32_bf16(F.kt[1], F.vt[1], Cacc, 0, 0, 0); \
        { v2u w; w.x = pk2(Cacc[0], Cacc[1]); w.y = pk2(Cacc[2], Cacc[3]); *(LAS v2u*)(CT + (cur ^ 1) * 1024 + c * 64 + 16 * wi + 4 * g) = w; } \
        { const size_t tb = (size_t)(n_) * 64 + 16 * wi + 4 * g; \
          if (sl < 8) { _Pragma("unroll") for (int r = 0; r < 4; ++r) HO[(tb + r) * BW + h * 128 + 16 * sl + c] = num[r]; } \
          else if (c == 0) { _Pragma("unroll") for (int r = 0; r < 4; ++r) HDEN[(tb + r) * 4 + h] = num[r]; } } \
        LDS_BAR(); } while (0)
    for (int n = 0; n < T / 64; n += 2) {
        ml_load(F1, p, (n + 1) * 4 + h, offA, offV);
        ML_STEP(F0, n);
        ml_load(F0, p, ((n + 2 < T / 64) ? n + 2 : n) * 4 + h, offA, offV);
        ML_STEP(F1, n + 1);
    }
#undef ML_STEP
}


constexpr int QP = 132;
__device__ __forceinline__ void gdn_pre_item(const Params& p, int l, LAS unsigned char* lds, int item, int tid, int wave, int lane) {
    const int h = item & 3, n = item >> 2; const size_t t0 = (size_t)n * 64;
    const bf16* Z = (const bf16*)(p.ws + WS_Z); const float* SMALL = (const float*)(p.ws + WS_SMALL);
    float* GU = (float*)(p.ws + WS_GU) + (size_t)item * 8192; bf16* GNW = (bf16*)(p.ws + WS_GNW) + (size_t)item * 8192; bf16* GQG = (bf16*)(p.ws + WS_GQG) + (size_t)item * 8192;
    bf16* GAT = (bf16*)(p.ws + WS_GAT) + (size_t)item * 4096; bf16* GKT = (bf16*)(p.ws + WS_GKT) + (size_t)item * 8192; float* GDL = (float*)(p.ws + WS_GDL);
    const float* cw = p.in[I_CONVW] + (size_t)l * 4 * 1536;
    LAS float* qs = (LAS float*)lds; LAS float* ks = qs + 64 * QP; LAS float* vs = ks + 64 * QP; LAS float* Ls = vs + 64 * QP;   LAS float* gcs = Ls + 64 * 68; LAS float* bts = gcs + 64; LAS float* btg = bts + 64;
    LAS unsigned short* zq = (LAS unsigned short*)(lds + 131584); LAS unsigned short* zk = (LAS unsigned short*)Ls; LAS unsigned short* zv = (LAS unsigned short*)vs; LAS float* cwl = btg + 64;
    float gate_b = 0.f, gate_a = 0.f; if (wave == 0) { gate_b = SMALL[(t0 + lane) * 16 + h]; gate_a = SMALL[(t0 + lane) * 16 + 4 + h]; }
    {   v4u zr[7]; v4f wr4 = (v4f){0.f, 0.f, 0.f, 0.f};
#pragma unroll
        for (int q = 0; q < 7; ++q) { const int idx = tid + 512 * q; zr[q] = (v4u){0u, 0u, 0u, 0u};
            if (idx < 3216) { const int seg = idx / 1072, rem = idx % 1072, r = rem >> 4, c16 = rem & 15; const long tt = (long)t0 - 3 + r;
                if (tt >= 0) zr[q] = *(const v4u*)(Z + (size_t)tt * ZC + ZC_GDN + seg * 512 + h * 128 + 8 * c16); } }
        if (tid < 384) { const int j = tid / 96, rest = tid % 96, i = rest >> 5, c4 = rest & 31; wr4 = *(const v4f*)(cw + j * 1536 + i * 512 + h * 128 + 4 * c4); }
#pragma unroll
        for (int q = 0; q < 7; ++q) { const int idx = tid + 512 * q;
            if (idx < 3216) { const int seg = idx / 1072, rem = idx % 1072; LAS unsigned short* zb = seg == 0 ? zq : (seg == 1 ? zk : zv); *(LAS v4u*)(zb + 8 * rem) = zr[q]; } }
        if (tid < 384) *(LAS v4f*)(cwl + 4 * tid) = wr4;
    }
    __syncthreads();
    { const int tk = tid >> 3, part = tid & 7; float av[16];
#pragma unroll 1
      for (int i = 0; i < 3; ++i) { float a[16]; const LAS unsigned short* zb = i == 0 ? zq : (i == 1 ? zk : zv);
#pragma unroll
        for (int x = 0; x < 16; ++x) a[x] = 0.f;
#pragma unroll
        for (int j = 0; j < 4; ++j) { const LAS unsigned short* src = zb + (tk + j) * 128 + 16 * part; float x0[8], x1[8]; unpack8(*(const LAS v4u*)src, x0); unpack8(*(const LAS v4u*)(src + 8), x1);
            const LAS float* wp = cwl + (j * 3 + i) * 128 + 16 * part;
#pragma unroll
            for (int x4 = 0; x4 < 2; ++x4) { const v4f w0 = *(const LAS v4f*)(wp + 4 * x4), w1 = *(const LAS v4f*)(wp + 8 + 4 * x4);
                a[4 * x4] += w0.x * x0[4 * x4]; a[4 * x4 + 1] += w0.y * x0[4 * x4 + 1]; a[4 * x4 + 2] += w0.z * x0[4 * x4 + 2]; a[4 * x4 + 3] += w0.w * x0[4 * x4 + 3];
                a[8 + 4 * x4] += w1.x * x1[4 * x4]; a[8 + 4 * x4 + 1] += w1.y * x1[4 * x4 + 1]; a[8 + 4 * x4 + 2] += w1.z * x1[4 * x4 + 2]; a[8 + 4 * x4 + 3] += w1.w * x1[4 * x4 + 3]; } }
        float ss = 0.f;
#pragma unroll
        for (int x = 0; x < 16; ++x) { a[x] = siluf_(a[x]); ss += a[x] * a[x]; }
        if (i < 2) { ss = sum8(ss); const float r = rsqrtf(ss + 1e-6f) * (i == 0 ? 0.08838834764831845f : 1.f);
#pragma unroll
            for (int x = 0; x < 16; ++x) a[x] *= r;
            LAS float* dst = (i == 0 ? qs : ks) + tk * QP + 16 * part;
#pragma unroll
            for (int x4 = 0; x4 < 4; ++x4) *(LAS v4f*)(dst + 4 * x4) = (v4f){a[4 * x4], a[4 * x4 + 1], a[4 * x4 + 2], a[4 * x4 + 3]}; }
        else {
#pragma unroll
            for (int x = 0; x < 16; ++x) av[x] = a[x]; } }
      __syncthreads();
      { LAS float* dst = vs + tk * QP + 16 * part;
#pragma unroll
        for (int x4 = 0; x4 < 4; ++x4) *(LAS v4f*)(dst + 4 * x4) = (v4f){av[4 * x4], av[4 * x4 + 1], av[4 * x4 + 2], av[4 * x4 + 3]}; } }
    if (wave == 0) { const float bb = gate_b, aa = gate_a;
        const float g = -__expf(p.in[I_ALOG][l * 4 + h]) * softplusf_(aa + p.in[I_DTB][l * 4 + h]);
        const float gc = wave_scan_incl(g), bt = sigmoidf_(bb); gcs[lane] = gc; bts[lane] = bt; btg[lane] = bt * __expf(gc); }
    __syncthreads();
    { const int ti = wave >> 1, c16 = lane & 15, g4 = lane >> 4, i = 16 * ti + c16; const float gi = gcs[i], bi = bts[i];
#define GDN_F8(dst, base) do { const v4f _a = *(const LAS v4f*)(base), _b = *(const LAS v4f*)((base) + 4); const v4u _w = (v4u){pg8::cvt_pk_bf16(_a.x, _a.y), pg8::cvt_pk_bf16(_a.z, _a.w), pg8::cvt_pk_bf16(_b.x, _b.y), pg8::cvt_pk_bf16(_b.z, _b.w)}; dst = __builtin_bit_cast(bf16x8_t, _w); } while (0)
      bf16x8_t bk[4], bq[4];
#pragma unroll
      for (int s4 = 0; s4 < 4; ++s4) { GDN_F8(bk[s4], ks + i * QP + 32 * s4 + 8 * g4); GDN_F8(bq[s4], qs + i * QP + 32 * s4 + 8 * g4); }
#pragma unroll
      for (int jj = 0; jj < 2; ++jj) { const int tj = 2 * (wave & 1) + jj; v4f lv = (v4f){0.f, 0.f, 0.f, 0.f}; v2u aw = (v2u){0u, 0u};
          if (tj <= ti) { pg8::f32x4 dk = {0.f, 0.f, 0.f, 0.f}, dq = {0.f, 0.f, 0.f, 0.f};
#pragma unroll
              for (int s4 = 0; s4 < 4; ++s4) { bf16x8_t a; GDN_F8(a, ks + (16 * tj + c16) * QP + 32 * s4 + 8 * g4);
                  dk = __builtin_amdgcn_mfma_f32_16x16x32_bf16(a, bk[s4], dk, 0, 0, 0); dq = __builtin_amdgcn_mfma_f32_16x16x32_bf16(a, bq[s4], dq, 0, 0, 0); }
              float l4[4], a4[4];
#pragma unroll
              for (int r = 0; r < 4; ++r) { const int j = 16 * tj + 4 * g4 + r; const float dc = __expf(gi - gcs[j]); l4[r] = (j < i) ? bi * dk[r] * dc : 0.f; a4[r] = (j <= i) ? dq[r] * dc : 0.f; }
              lv = (v4f){l4[0], l4[1], l4[2], l4[3]}; aw = (v2u){pk2(a4[0], a4[1]), pk2(a4[2], a4[3])}; }
          *(LAS v4f*)(Ls + i * 68 + 16 * tj + 4 * g4) = lv; *(v2u*)(GAT + i * 64 + 16 * tj + 4 * g4) = aw; }
#undef GDN_F8
    }
    __syncthreads();
    if (tid < 256) {
        const int c = tid; int vz; asm volatile("v_mov_b32 %0, 0" : "=v"(vz));
        const LAS float* rp = (c < 128) ? (vs + c) : (ks + (c - 128)); const LAS float* mp = ((c < 128) ? bts : btg) + vz;
#define GDN_RHS(i) (rp[(i) * QP] * mp[(i)])
#define GDN_L4(i, j4) (*(const LAS v4f*)(Ls + (i) * 68 + 4 * (j4) + vz))
        float x0 = GDN_RHS(0); __builtin_amdgcn_sched_barrier(0);
        float x1 = GDN_RHS(1); { const v4f l0 = GDN_L4(1, 0); __builtin_amdgcn_sched_barrier(0); x1 -= l0.x * x0; } __builtin_amdgcn_sched_barrier(0);
        float x2 = GDN_RHS(2); { const v4f l0 = GDN_L4(2, 0); __builtin_amdgcn_sched_barrier(0); x2 -= l0.x * x0; x2 -= l0.y * x1; } __builtin_amdgcn_sched_barrier(0);
        float x3 = GDN_RHS(3); { const v4f l0 = GDN_L4(3, 0); __builtin_amdgcn_sched_barrier(0); x3 -= l0.x * x0; x3 -= l0.y * x1; x3 -= l0.z * x2; } __builtin_amdgcn_sched_barrier(0);
        float x4 = GDN_RHS(4); { const v4f l0 = GDN_L4(4, 0); __builtin_amdgcn_sched_barrier(0); x4 -= l0.x * x0; x4 -= l0.y * x1; x4 -= l0.z * x2; x4 -= l0.w * x3; } __builtin_amdgcn_sched_barrier(0);
        float x5 = GDN_RHS(5); { const v4f l0 = GDN_L4(5, 0); const v4f l1 = GDN_L4(5, 1); __builtin_amdgcn_sched_barrier(0); x5 -= l0.x * x0; x5 -= l0.y * x1; x5 -= l0.z * x2; x5 -= l0.w * x3; x5 -= l1.x * x4; } __builtin_amdgcn_sched_barrier(0);
        float x6 = GDN_RHS(6); { const v4f l0 = GDN_L4(6, 0); const v4f l1 = GDN_L4(6, 1); __builtin_amdgcn_sched_barrier(0); x6 -= l0.x * x0; x6 -= l0.y * x1; x6 -= l0.z * x2; x6 -= l0.w * x3; x6 -= l1.x * x4; x6 -= l1.y * x5; } __builtin_amdgcn_sched_barrier(0);
        float x7 = GDN_RHS(7); { const v4f l0 = GDN_L4(7, 0); const v4f l1 = GDN_L4(7, 1); __builtin_amdgcn_sched_barrier(0); x7 -= l0.x * x0; x7 -= l0.y * x1; x7 -= l0.z * x2; x7 -= l0.w * x3; x7 -= l1.x * x4; x7 -= l1.y * x5; x7 -= l1.z * x6; } __builtin_amdgcn_sched_barrier(0);
        float x8 = GDN_RHS(8); { const v4f l0 = GDN_L4(8, 0); const v4f l1 = GDN_L4(8, 1); __builtin_amdgcn_sched_barrier(0); x8 -= l0.x * x0; x8 -= l0.y * x1; x8 -= l0.z * x2; x8 -= l0.w * x3; x8 -= l1.x * x4; x8 -= l1.y * x5; x8 -= l1.z * x6; x8 -= l1.w * x7; } __builtin_amdgcn_sched_barrier(0);
        float x9 = GDN_RHS(9); { const v4f l0 = GDN_L4(9, 0); const v4f l1 = GDN_L4(9, 1); const v4f l2 = GDN_L4(9, 2); __builtin_amdgcn_sched_barrier(0); x9 -= l0.x * x0; x9 -= l0.y * x1; x9 -= l0.z * x2; x9 -= l0.w * x3; x9 -= l1.x * x4; x9 -= l1.y * x5; x9 -= l1.z * x6; x9 -= l1.w * x7; x9 -= l2.x * x8; } __builtin_amdgcn_sched_barrier(0);
        float x10 = GDN_RHS(10); { const v4f l0 = GDN_L4(10, 0); const v4f l1 = GDN_L4(10, 1); const v4f l2 = GDN_L4(10, 2); __builtin_amdgcn_sched_barrier(0); x10 -= l0.x * x0; x10 -= l0.y * x1; x10 -= l0.z * x2; x10 -= l0.w * x3; x10 -= l1.x * x4; x10 -= l1.y * x5; x10 -= l1.z * x6; x10 -= l1.w * x7; x10 -= l2.x * x8; x10 -= l2.y * x9; } __builtin_amdgcn_sched_barrier(0);
        float x11 = GDN_RHS(11); { const v4f l0 = GDN_L4(11, 0); const v4f l1 = GDN_L4(11, 1); const v4f l2 = GDN_L4(11, 2); __builtin_amdgcn_sched_barrier(0); x11 -= l0.x * x0; x11 -= l0.y * x1; x11 -= l0.z * x2; x11 -= l0.w * x3; x11 -= l1.x * x4; x11 -= l1.y * x5; x11 -= l1.z * x6; x11 -= l1.w * x7; x11 -= l2.x * x8; x11 -= l2.y * x9; x11 -= l2.z * x10; } __builtin_amdgcn_sched_barrier(0);
        float x12 = GDN_RHS(12); { const v4f l0 = GDN_L4(12, 0); const v4f l1 = GDN_L4(12, 1); const v4f l2 = GDN_L4(12, 2); __builtin_amdgcn_sched_barrier(0); x12 -= l0.x * x0; x12 -= l0.y * x1; x12 -= l0.z * x2; x12 -= l0.w * x3; x12 -= l1.x * x4; x12 -= l1.y * x5; x12 -= l1.z * x6; x12 -= l1.w * x7; x12 -= l2.x * x8; x12 -= l2.y * x9; x12 -= l2.z * x10; x12 -= l2.w * x11; } __builtin_amdgcn_sched_barrier(0);
        float x13 = GDN_RHS(13); { const v4f l0 = GDN_L4(13, 0); const v4f l1 = GDN_L4(13, 1); const v4f l2 = GDN_L4(13, 2); const v4f l3 = GDN_L4(13, 3); __builtin_amdgcn_sched_barrier(0); x13 -= l0.x * x0; x13 -= l0.y * x1; x13 -= l0.z * x2; x13 -= l0.w * x3; x13 -= l1.x * x4; x13 -= l1.y * x5; x13 -= l1.z * x6; x13 -= l1.w * x7; x13 -= l2.x * x8; x13 -= l2.y * x9; x13 -= l2.z * x10; x13 -= l2.w * x11; x13 -= l3.x * x12; } __builtin_amdgcn_sched_barrier(0);
        float x14 = GDN_RHS(14); { const v4f l0 = GDN_L4(14, 0); const v4f l1 = GDN_L4(14, 1); const v4f l2 = GDN_L4(14, 2); const v4f l3 = GDN_L4(14, 3); __builtin_amdgcn_sched_barrier(0); x14 -= l0.x * x0; x14 -= l0.y * x1; x14 -= l0.z * x2; x14 -= l0.w * x3; x14 -= l1.x * x4; x14 -= l1.y * x5; x14 -= l1.z * x6; x14 -= l1.w * x7; x14 -= l2.x * x8; x14 -= l2.y * x9; x14 -= l2.z * x10; x14 -= l2.w * x11; x14 -= l3.x * x12; x14 -= l3.y * x13; } __builtin_amdgcn_sched_barrier(0);
        float x15 = GDN_RHS(15); { const v4f l0 = GDN_L4(15, 0); const v4f l1 = GDN_L4(15, 1); const v4f l2 = GDN_L4(15, 2); const v4f l3 = GDN_L4(15, 3); __builtin_amdgcn_sched_barrier(0); x15 -= l0.x * x0; x15 -= l0.y * x1; x15 -= l0.z * x2; x15 -= l0.w * x3; x15 -= l1.x * x4; x15 -= l1.y * x5; x15 -= l1.z * x6; x15 -= l1.w * x7; x15 -= l2.x * x8; x15 -= l2.y * x9; x15 -= l2.z * x10; x15 -= l2.w * x11; x15 -= l3.x * x12; x15 -= l3.y * x13; x15 -= l3.z * x14; } __builtin_amdgcn_sched_barrier(0);
        float x16 = GDN_RHS(16); { const v4f l0 = GDN_L4(16, 0); const v4f l1 = GDN_L4(16, 1); const v4f l2 = GDN_L4(16, 2); const v4f l3 = GDN_L4(16, 3); __builtin_amdgcn_sched_barrier(0); x16 -= l0.x * x0; x16 -= l0.y * x1; x16 -= l0.z * x2; x16 -= l0.w * x3; x16 -= l1.x * x4; x16 -= l1.y * x5; x16 -= l1.z * x6; x16 -= l1.w * x7; x16 -= l2.x * x8; x16 -= l2.y * x9; x16 -= l2.z * x10; x16 -= l2.w * x11; x16 -= l3.x * x12; x16 -= l3.y * x13; x16 -= l3.z * x14; x16 -= l3.w * x15; } __builtin_amdgcn_sched_barrier(0);
        float x17 = GDN_RHS(17); { const v4f l0 = GDN_L4(17, 0); const v4f l1 = GDN_L4(17, 1); const v4f l2 = GDN_L4(17, 2); const v4f l3 = GDN_L4(17, 3); const v4f l4 = GDN_L4(17, 4); __builtin_amdgcn_sched_barrier(0); x17 -= l0.x * x0; x17 -= l0.y * x1; x17 -= l0.z * x2; x17 -= l0.w * x3; x17 -= l1.x * x4; x17 -= l1.y * x5; x17 -= l1.z * x6; x17 -= l1.w * x7; x17 -= l2.x * x8; x17 -= l2.y * x9; x17 -= l2.z * x10; x17 -= l2.w * x11; x17 -= l3.x * x12; x17 -= l3.y * x13; x17 -= l3.z * x14; x17 -= l3.w * x15; x17 -= l4.x * x16; } __builtin_amdgcn_sched_barrier(0);
        float x18 = GDN_RHS(18); { const v4f l0 = GDN_L4(18, 0); const v4f l1 = GDN_L4(18, 1); const v4f l2 = GDN_L4(18, 2); const v4f l3 = GDN_L4(18, 3); const v4f l4 = GDN_L4(18, 4); __builtin_amdgcn_sched_barrier(0); x18 -= l0.x * x0; x18 -= l0.y * x1; x18 -= l0.z * x2; x18 -= l0.w * x3; x18 -= l1.x * x4; x18 -= l1.y * x5; x18 -= l1.z * x6; x18 -= l1.w * x7; x18 -= l2.x * x8; x18 -= l2.y * x9; x18 -= l2.z * x10; x18 -= l2.w * x11; x18 -= l3.x * x12; x18 -= l3.y * x13; x18 -= l3.z * x14; x18 -= l3.w * x15; x18 -= l4.x * x16; x18 -= l4.y * x17; } __builtin_amdgcn_sched_barrier(0);
        float x19 = GDN_RHS(19); { const v4f l0 = GDN_L4(19, 0); const v4f l1 = GDN_L4(19, 1); const v4f l2 = GDN_L4(19, 2); const v4f l3 = GDN_L4(19, 3); const v4f l4 = GDN_L4(19, 4); __builtin_amdgcn_sched_barrier(0); x19 -= l0.x * x0; x19 -= l0.y * x1; x19 -= l0.z * x2; x19 -= l0.w * x3; x19 -= l1.x * x4; x19 -= l1.y * x5; x19 -= l1.z * x6; x19 -= l1.w * x7; x19 -= l2.x * x8; x19 -= l2.y * x9; x19 -= l2.z * x10; x19 -= l2.w * x11; x19 -= l3.x * x12; x19 -= l3.y * x13; x19 -= l3.z * x14; x19 -= l3.w * x15; x19 -= l4.x * x16; x19 -= l4.y * x17; x19 -= l4.z * x18; } __builtin_amdgcn_sched_barrier(0);
        float x20 = GDN_RHS(20); { const v4f l0 = GDN_L4(20, 0); const v4f l1 = GDN_L4(20, 1); const v4f l2 = GDN_L4(20, 2); const v4f l3 = GDN_L4(20, 3); const v4f l4 = GDN_L4(20, 4); __builtin_amdgcn_sched_barrier(0); x20 -= l0.x * x0; x20 -= l0.y * x1; x20 -= l0.z * x2; x20 -= l0.w * x3; x20 -= l1.x * x4; x20 -= l1.y * x5; x20 -= l1.z * x6; x20 -= l1.w * x7; x20 -= l2.x * x8; x20 -= l2.y * x9; x20 -= l2.z * x10; x20 -= l2.w * x11; x20 -= l3.x * x12; x20 -= l3.y * x13; x20 -= l3.z * x14; x20 -= l3.w * x15; x20 -= l4.x * x16; x20 -= l4.y * x17; x20 -= l4.z * x18; x20 -= l4.w * x19; } __builtin_amdgcn_sched_barrier(0);
        float x21 = GDN_RHS(21); { const v4f l0 = GDN_L4(21, 0); const v4f l1 = GDN_L4(21, 1); const v4f l2 = GDN_L4(21, 2); const v4f l3 = GDN_L4(21, 3); const v4f l4 = GDN_L4(21, 4); const v4f l5 = GDN_L4(21, 5); __builtin_amdgcn_sched_barrier(0); x21 -= l0.x * x0; x21 -= l0.y * x1; x21 -= l0.z * x2; x21 -= l0.w * x3; x21 -= l1.x * x4; x21 -= l1.y * x5; x21 -= l1.z * x6; x21 -= l1.w * x7; x21 -= l2.x * x8; x21 -= l2.y * x9; x21 -= l2.z * x10; x21 -= l2.w * x11; x21 -= l3.x * x12; x21 -= l3.y * x13; x21 -= l3.z * x14; x21 -= l3.w * x15; x21 -= l4.x * x16; x21 -= l4.y * x17; x21 -= l4.z * x18; x21 -= l4.w * x19; x21 -= l5.x * x20; } __builtin_amdgcn_sched_barrier(0);
        float x22 = GDN_RHS(22); { const v4f l0 = GDN_L4(22, 0); const v4f l1 = GDN_L4(22, 1); const v4f l2 = GDN_L4(22, 2); const v4f l3 = GDN_L4(22, 3); const v4f l4 = GDN_L4(22, 4); const v4f l5 = GDN_L4(22, 5); __builtin_amdgcn_sched_barrier(0); x22 -= l0.x * x0; x22 -= l0.y * x1; x22 -= l0.z * x2; x22 -= l0.w * x3; x22 -= l1.x * x4; x22 -= l1.y * x5; x22 -= l1.z * x6; x22 -= l1.w * x7; x22 -= l2.x * x8; x22 -= l2.y * x9; x22 -= l2.z * x10; x22 -= l2.w * x11; x22 -= l3.x * x12; x22 -= l3.y * x13; x22 -= l3.z * x14; x22 -= l3.w * x15; x22 -= l4.x * x16; x22 -= l4.y * x17; x22 -= l4.z * x18; x22 -= l4.w * x19; x22 -= l5.x * x20; x22 -= l5.y * x21; } __builtin_amdgcn_sched_barrier(0);
        float x23 = GDN_RHS(23); { const v4f l0 = GDN_L4(23, 0); const v4f l1 = GDN_L4(23, 1); const v4f l2 = GDN_L4(23, 2); const v4f l3 = GDN_L4(23, 3); const v4f l4 = GDN_L4(23, 4); const v4f l5 = GDN_L4(23, 5); __builtin_amdgcn_sched_barrier(0); x23 -= l0.x * x0; x23 -= l0.y * x1; x23 -= l0.z * x2; x23 -= l0.w * x3; x23 -= l1.x * x4; x23 -= l1.y * x5; x23 -= l1.z * x6; x23 -= l1.w * x7; x23 -= l2.x * x8; x23 -= l2.y * x9; x23 -= l2.z * x10; x23 -= l2.w * x11; x23 -= l3.x * x12; x23 -= l3.y * x13; x23 -= l3.z * x14; x23 -= l3.w * x15; x23 -= l4.x * x16; x23 -= l4.y * x17; x23 -= l4.z * x18; x23 -= l4.w * x19; x23 -= l5.x * x20; x23 -= l5.y * x21; x23 -= l5.z * x22; } __builtin_amdgcn_sched_barrier(0);
        float x24 = GDN_RHS(24); { const v4f l0 = GDN_L4(24, 0); const v4f l1 = GDN_L4(24, 1); const v4f l2 = GDN_L4(24, 2); const v4f l3 = GDN_L4(24, 3); const v4f l4 = GDN_L4(24, 4); const v4f l5 = GDN_L4(24, 5); __builtin_amdgcn_sched_barrier(0); x24 -= l0.x * x0; x24 -= l0.y * x1; x24 -= l0.z * x2; x24 -= l0.w * x3; x24 -= l1.x * x4; x24 -= l1.y * x5; x24 -= l1.z * x6; x24 -= l1.w * x7; x24 -= l2.x * x8; x24 -= l2.y * x9; x24 -= l2.z * x10; x24 -= l2.w * x11; x24 -= l3.x * x12; x24 -= l3.y * x13; x24 -= l3.z * x14; x24 -= l3.w * x15; x24 -= l4.x * x16; x24 -= l4.y * x17; x24 -= l4.z * x18; x24 -= l4.w * x19; x24 -= l5.x * x20; x24 -= l5.y * x21; x24 -= l5.z * x22; x24 -= l5.w * x23; } __builtin_amdgcn_sched_barrier(0);
        float x25 = GDN_RHS(25); { const v4f l0 = GDN_L4(25, 0); const v4f l1 = GDN_L4(25, 1); const v4f l2 = GDN_L4(25, 2); const v4f l3 = GDN_L4(25, 3); const v4f l4 = GDN_L4(25, 4); const v4f l5 = GDN_L4(25, 5); __builtin_amdgcn_sched_barrier(0); x25 -= l0.x * x0; x25 -= l0.y * x1; x25 -= l0.z * x2; x25 -= l0.w * x3; x25 -= l1.x * x4; x25 -= l1.y * x5; x25 -= l1.z * x6; x25 -= l1.w * x7; x25 -= l2.x * x8; x25 -= l2.y * x9; x25 -= l2.z * x10; x25 -= l2.w * x11; x25 -= l3.x * x12; x25 -= l3.y * x13; x25 -= l3.z * x14; x25 -= l3.w * x15; x25 -= l4.x * x16; x25 -= l4.y * x17; x25 -= l4.z * x18; x25 -= l4.w * x19; x25 -= l5.x * x20; x25 -= l5.y * x21; x25 -= l5.z * x22; x25 -= l5.w * x23; } __builtin_amdgcn_sched_barrier(0); { const v4f l6 = GDN_L4(25, 6); __builtin_amdgcn_sched_barrier(0); x25 -= l6.x * x24; } __builtin_amdgcn_sched_barrier(0);
        float x26 = GDN_RHS(26); { const v4f l0 = GDN_L4(26, 0); const v4f l1 = GDN_L4(26, 1); const v4f l2 = GDN_L4(26, 2); const v4f l3 = GDN_L4(26, 3); const v4f l4 = GDN_L4(26, 4); const v4f l5 = GDN_L4(26, 5); __builtin_amdgcn_sched_barrier(0); x26 -= l0.x * x0; x26 -= l0.y * x1; x26 -= l0.z * x2; x26 -= l0.w * x3; x26 -= l1.x * x4; x26 -= l1.y * x5; x26 -= l1.z * x6; x26 -= l1.w * x7; x26 -= l2.x * x8; x26 -= l2.y * x9; x26 -= l2.z * x10; x26 -= l2.w * x11; x26 -= l3.x * x12; x26 -= l3.y * x13; x26 -= l3.z * x14; x26 -= l3.w * x15; x26 -= l4.x * x16; x26 -= l4.y * x17; x26 -= l4.z * x18; x26 -= l4.w * x19; x26 -= l5.x * x20; x26 -= l5.y * x21; x26 -= l5.z * x22; x26 -= l5.w * x23; } __builtin_amdgcn_sched_barrier(0); { const v4f l6 = GDN_L4(26, 6); __builtin_amdgcn_sched_barrier(0); x26 -= l6.x * x24; x26 -= l6.y * x25; } __builtin_amdgcn_sched_barrier(0);
        float x27 = GDN_RHS(27); { const v4f l0 = GDN_L4(27, 0); const v4f l1 = GDN_L4(27, 1); const v4f l2 = GDN_L4(27, 2); const v4f l3 = GDN_L4(27, 3); const v4f l4 = GDN_L4(27, 4); const v4f l5 = GDN_L4(27, 5); __builtin_amdgcn_sched_barrier(0); x27 -= l0.x * x0; x27 -= l0.y * x1; x27 -= l0.z * x2; x27 -= l0.w * x3; x27 -= l1.x * x4; x27 -= l1.y * x5; x27 -= l1.z * x6; x27 -= l1.w * x7; x27 -= l2.x * x8; x27 -= l2.y * x9; x27 -= l2.z * x10; x27 -= l2.w * x11; x27 -= l3.x * x12; x27 -= l3.y * x13; x27 -= l3.z * x14; x27 -= l3.w * x15; x27 -= l4.x * x16; x27 -= l4.y * x17; x27 -= l4.z * x18; x27 -= l4.w * x19; x27 -= l5.x * x20; x27 -= l5.y * x21; x27 -= l5.z * x22; x27 -= l5.w * x23; } __builtin_amdgcn_sched_barrier(0); { const v4f l6 = GDN_L4(27, 6); __builtin_amdgcn_sched_barrier(0); x27 -= l6.x * x24; x27 -= l6.y * x25; x27 -= l6.z * x26; } __builtin_amdgcn_sched_barrier(0);
        float x28 = GDN_RHS(28); { const v4f l0 = GDN_L4(28, 0); const v4f l1 = GDN_L4(28, 1); const v4f l2 = GDN_L4(28, 2); const v4f l3 = GDN_L4(28, 3); const v4f l4 = GDN_L4(28, 4); const v4f l5 = GDN_L4(28, 5); __builtin_amdgcn_sched_barrier(0); x28 -= l0.x * x0; x28 -= l0.y * x1; x28 -= l0.z * x2; x28 -= l0.w * x3; x28 -= l1.x * x4; x28 -= l1.y * x5; x28 -= l1.z * x6; x28 -= l1.w * x7; x28 -= l2.x * x8; x28 -= l2.y * x9; x28 -= l2.z * x10; x28 -= l2.w * x11; x28 -= l3.x * x12; x28 -= l3.y * x13; x28 -= l3.z * x14; x28 -= l3.w * x15; x28 -= l4.x * x16; x28 -= l4.y * x17; x28 -= l4.z * x18; x28 -= l4.w * x19; x28 -= l5.x * x20; x28 -= l5.y * x21; x28 -= l5.z * x22; x28 -= l5.w * x23; } __builtin_amdgcn_sched_barrier(0); { const v4f l6 = GDN_L4(28, 6); __builtin_amdgcn_sched_barrier(0); x28 -= l6.x * x24; x28 -= l6.y * x25; x28 -= l6.z * x26; x28 -= l6.w * x27; } __builtin_amdgcn_sched_barrier(0);
        float x29 = GDN_RHS(29); { const v4f l0 = GDN_L4(29, 0); const v4f l1 = GDN_L4(29, 1); const v4f l2 = GDN_L4(29, 2); const v4f l3 = GDN_L4(29, 3); const v4f l4 = GDN_L4(29, 4); const v4f l5 = GDN_L4(29, 5); __builtin_amdgcn_sched_barrier(0); x29 -= l0.x * x0; x29 -= l0.y * x1; x29 -= l0.z * x2; x29 -= l0.w * x3; x29 -= l1.x * x4; x29 -= l1.y * x5; x29 -= l1.z * x6; x29 -= l1.w * x7; x29 -= l2.x * x8; x29 -= l2.y * x9; x29 -= l2.z * x10; x29 -= l2.w * x11; x29 -= l3.x * x12; x29 -= l3.y * x13; x29 -= l3.z * x14; x29 -= l3.w * x15; x29 -= l4.x * x16; x29 -= l4.y * x17; x29 -= l4.z * x18; x29 -= l4.w * x19; x29 -= l5.x * x20; x29 -= l5.y * x21; x29 -= l5.z * x22; x29 -= l5.w * x23; } __builtin_amdgcn_sched_barrier(0); { const v4f l6 = GDN_L4(29, 6); const v4f l7 = GDN_L4(29, 7); __builtin_amdgcn_sched_barrier(0); x29 -= l6.x * x24; x29 -= l6.y * x25; x29 -= l6.z * x26; x29 -= l6.w * x27; x29 -= l7.x * x28; } __builtin_amdgcn_sched_barrier(0);
        float x30 = GDN_RHS(30); { const v4f l0 = GDN_L4(30, 0); const v4f l1 = GDN_L4(30, 1); const v4f l2 = GDN_L4(30, 2); const v4f l3 = GDN_L4(30, 3); const v4f l4 = GDN_L4(30, 4); const v4f l5 = GDN_L4(30, 5); __builtin_amdgcn_sched_barrier(0); x30 -= l0.x * x0; x30 -= l0.y * x1; x30 -= l0.z * x2; x30 -= l0.w * x3; x30 -= l1.x * x4; x30 -= l1.y * x5; x30 -= l1.z * x6; x30 -= l1.w * x7; x30 -= l2.x * x8; x30 -= l2.y * x9; x30 -= l2.z * x10; x30 -= l2.w * x11; x30 -= l3.x * x12; x30 -= l3.y * x13; x30 -= l3.z * x14; x30 -= l3.w * x15; x30 -= l4.x * x16; x30 -= l4.y * x17; x30 -= l4.z * x18; x30 -= l4.w * x19; x30 -= l5.x * x20; x30 -= l5.y * x21; x30 -= l5.z * x22; x30 -= l5.w * x23; } __builtin_amdgcn_sched_barrier(0); { const v4f l6 = GDN_L4(30, 6); const v4f l7 = GDN_L4(30, 7); __builtin_amdgcn_sched_barrier(0); x30 -= l6.x * x24; x30 -= l6.y * x25; x30 -= l6.z * x26; x30 -= l6.w * x27; x30 -= l7.x * x28; x30 -= l7.y * x29; } __builtin_amdgcn_sched_barrier(0);
        float x31 = GDN_RHS(31); { const v4f l0 = GDN_L4(31, 0); const v4f l1 = GDN_L4(31, 1); const v4f l2 = GDN_L4(31, 2); const v4f l3 = GDN_L4(31, 3); const v4f l4 = GDN_L4(31, 4); const v4f l5 = GDN_L4(31, 5); __builtin_amdgcn_sched_barrier(0); x31 -= l0.x * x0; x31 -= l0.y * x1; x31 -= l0.z * x2; x31 -= l0.w * x3; x31 -= l1.x * x4; x31 -= l1.y * x5; x31 -= l1.z * x6; x31 -= l1.w * x7; x31 -= l2.x * x8; x31 -= l2.y * x9; x31 -= l2.z * x10; x31 -= l2.w * x11; x31 -= l3.x * x12; x31 -= l3.y * x13; x31 -= l3.z * x14; x31 -= l3.w * x15; x31 -= l4.x * x16; x31 -= l4.y * x17; x31 -= l4.z * x18; x31 -= l4.w * x19; x31 -= l5.x * x20; x31 -= l5.y * x21; x31 -= l5.z * x22; x31 -= l5.w * x23; } __builtin_amdgcn_sched_barrier(0); { const v4f l6 = GDN_L4(31, 6); const v4f l7 = GDN_L4(31, 7); __builtin_amdgcn_sched_barrier(0); x31 -= l6.x * x24; x31 -= l6.y * x25; x31 -= l6.z * x26; x31 -= l6.w * x27; x31 -= l7.x * x28; x31 -= l7.y * x29; x31 -= l7.z * x30; } __builtin_amdgcn_sched_barrier(0);
        float x32 = GDN_RHS(32); { const v4f l0 = GDN_L4(32, 0); const v4f l1 = GDN_L4(32, 1); const v4f l2 = GDN_L4(32, 2); const v4f l3 = GDN_L4(32, 3); const v4f l4 = GDN_L4(32, 4); const v4f l5 = GDN_L4(32, 5); __builtin_amdgcn_sched_barrier(0); x32 -= l0.x * x0; x32 -= l0.y * x1; x32 -= l0.z * x2; x32 -= l0.w * x3; x32 -= l1.x * x4; x32 -= l1.y * x5; x32 -= l1.z * x6; x32 -= l1.w * x7; x32 -= l2.x * x8; x32 -= l2.y * x9; x32 -= l2.z * x10; x32 -= l2.w * x11; x32 -= l3.x * x12; x32 -= l3.y * x13; x32 -= l3.z * x14; x32 -= l3.w * x15; x32 -= l4.x * x16; x32 -= l4.y * x17; x32 -= l4.z * x18; x32 -= l4.w * x19; x32 -= l5.x * x20; x32 -= l5.y * x21; x32 -= l5.z * x22; x32 -= l5.w * x23; } __builtin_amdgcn_sched_barrier(0); { const v4f l6 = GDN_L4(32, 6); const v4f l7 = GDN_L4(32, 7); __builtin_amdgcn_sched_barrier(0); x32 -= l6.x * x24; x32 -= l6.y * x25; x32 -= l6.z * x26; x32 -= l6.w * x27; x32 -= l7.x * x28; x32 -= l7.y * x29; x32 -= l7.z * x30; x32 -= l7.w * x31; } __builtin_amdgcn_sched_barrier(0);
        float x33 = GDN_RHS(33); { const v4f l0 = GDN_L4(33, 0); const v4f l1 = GDN_L4(33, 1); const v4f l2 = GDN_L4(33, 2); const v4f l3 = GDN_L4(33, 3); const v4f l4 = GDN_L4(33, 4); const v4f l5 = GDN_L4(33, 5); __builtin_amdgcn_sched_barrier(0); x33 -= l0.x * x0; x33 -= l0.y * x1; x33 -= l0.z * x2; x33 -= l0.w * x3; x33 -= l1.x * x4; x33 -= l1.y * x5; x33 -= l1.z * x6; x33 -= l1.w * x7; x33 -= l2.x * x8; x33 -= l2.y * x9; x33 -= l2.z * x10; x33 -= l2.w * x11; x33 -= l3.x * x12; x33 -= l3.y * x13; x33 -= l3.z * x14; x33 -= l3.w * x15; x33 -= l4.x * x16; x33 -= l4.y * x17; x33 -= l4.z * x18; x33 -= l4.w * x19; x33 -= l5.x * x20; x33 -= l5.y * x21; x33 -= l5.z * x22; x33 -= l5.w * x23; } __builtin_amdgcn_sched_barrier(0); { const v4f l6 = GDN_L4(33, 6); const v4f l7 = GDN_L4(33, 7); const v4f l8 = GDN_L4(33, 8); __builtin_amdgcn_sched_barrier(0); x33 -= l6.x * x24; x33 -= l6.y * x25; x33 -= l6.z * x26; x33 -= l6.w * x27; x33 -= l7.x * x28; x33 -= l7.y * x29; x33 -= l7.z * x30; x33 -= l7.w * x31; x33 -= l8.x * x32; } __builtin_amdgcn_sched_barrier(0);
        float x34 = GDN_RHS(34); { const v4f l0 = GDN_L4(34, 0); const v4f l1 = GDN_L4(34, 1); const v4f l2 = GDN_L4(34, 2); const v4f l3 = GDN_L4(34, 3); const v4f l4 = GDN_L4(34, 4); const v4f l5 = GDN_L4(34, 5); __builtin_amdgcn_sched_barrier(0); x34 -= l0.x * x0; x34 -= l0.y * x1; x34 -= l0.z * x2; x34 -= l0.w * x3; x34 -= l1.x * x4; x34 -= l1.y * x5; x34 -= l1.z * x6; x34 -= l1.w * x7; x34 -= l2.x * x8; x34 -= l2.y * x9; x34 -= l2.z * x10; x34 -= l2.w * x11; x34 -= l3.x * x12; x34 -= l3.y * x13; x34 -= l3.z * x14; x34 -= l3.w * x15; x34 -= l4.x * x16; x34 -= l4.y * x17; x34 -= l4.z * x18; x34 -= l4.w * x19; x34 -= l5.x * x20; x34 -= l5.y * x21; x34 -= l5.z * x22; x34 -= l5.w * x23; } __builtin_amdgcn_sched_barrier(0); { const v4f l6 = GDN_L4(34, 6); const v4f l7 = GDN_L4(34, 7); const v4f l8 = GDN_L4(34, 8); __builtin_amdgcn_sched_barrier(0); x34 -= l6.x * x24; x34 -= l6.y * x25; x34 -= l6.z * x26; x34 -= l6.w * x27; x34 -= l7.x * x28; x34 -= l7.y * x29; x34 -= l7.z * x30; x34 -= l7.w * x31; x34 -= l8.x * x32; x34 -= l8.y * x33; } __builtin_amdgcn_sched_barrier(0);
        float x35 = GDN_RHS(35); { const v4f l0 = GDN_L4(35, 0); const v4f l1 = GDN_L4(35, 1); const v4f l2 = GDN_L4(35, 2); const v4f l3 = GDN_L4(35, 3); const v4f l4 = GDN_L4(35, 4); const v4f l5 = GDN_L4(35, 5); __builtin_amdgcn_sched_barrier(0); x35 -= l0.x * x0; x35 -= l0.y * x1; x35 -= l0.z * x2; x35 -= l0.w * x3; x35 -= l1.x * x4; x35 -= l1.y * x5; x35 -= l1.z * x6; x35 -= l1.w * x7; x35 -= l2.x * x8; x35 -= l2.y * x9; x35 -= l2.z * x10; x35 -= l2.w * x11; x35 -= l3.x * x12; x35 -= l3.y * x13; x35 -= l3.z * x14; x35 -= l3.w * x15; x35 -= l4.x * x16; x35 -= l4.y * x17; x35 -= l4.z * x18; x35 -= l4.w * x19; x35 -= l5.x * x20; x35 -= l5.y * x21; x35 -= l5.z * x22; x35 -= l5.w * x23; } __builtin_amdgcn_sched_barrier(0); { const v4f l6 = GDN_L4(35, 6); const v4f l7 = GDN_L4(35, 7); const v4f l8 = GDN_L4(35, 8); __builtin_amdgcn_sched_barrier(0); x35 -= l6.x * x24; x35 -= l6.y * x25; x35 -= l6.z * x26; x35 -= l6.w * x27; x35 -= l7.x * x28; x35 -= l7.y * x29; x35 -= l7.z * x30; x35 -= l7.w * x31; x35 -= l8.x * x32; x35 -= l8.y * x33; x35 -= l8.z * x34; } __builtin_amdgcn_sched_barrier(0);
        float x36 = GDN_RHS(36); { const v4f l0 = GDN_L4(36, 0); const v4f l1 = GDN_L4(36, 1); const v4f l2 = GDN_L4(36, 2); const v4f l3 = GDN_L4(36, 3); const v4f l4 = GDN_L4(36, 4); const v4f l5 = GDN_L4(36, 5); __builtin_amdgcn_sched_barrier(0); x36 -= l0.x * x0; x36 -= l0.y * x1; x36 -= l0.z * x2; x36 -= l0.w * x3; x36 -= l1.x * x4; x36 -= l1.y * x5; x36 -= l1.z * x6; x36 -= l1.w * x7; x36 -= l2.x * x8; x36 -= l2.y * x9; x36 -= l2.z * x10; x36 -= l2.w * x11; x36 -= l3.x * x12; x36 -= l3.y * x13; x36 -= l3.z * x14; x36 -= l3.w * x15; x36 -= l4.x * x16; x36 -= l4.y * x17; x36 -= l4.z * x18; x36 -= l4.w * x19; x36 -= l5.x * x20; x36 -= l5.y * x21; x36 -= l5.z * x22; x36 -= l5.w * x23; } __builtin_amdgcn_sched_barrier(0); { const v4f l6 = GDN_L4(36, 6); const v4f l7 = GDN_L4(36, 7); const v4f l8 = GDN_L4(36, 8); __builtin_amdgcn_sched_barrier(0); x36 -= l6.x * x24; x36 -= l6.y * x25; x36 -= l6.z * x26; x36 -= l6.w * x27; x36 -= l7.x * x28; x36 -= l7.y * x29; x36 -= l7.z * x30; x36 -= l7.w * x31; x36 -= l8.x * x32; x36 -= l8.y * x33; x36 -= l8.z * x34; x36 -= l8.w * x35; } __builtin_amdgcn_sched_barrier(0);
        float x37 = GDN_RHS(37); { const v4f l0 = GDN_L4(37, 0); const v4f l1 = GDN_L4(37, 1); const v4f l2 = GDN_L4(37, 2); const v4f l3 = GDN_L4(37, 3); const v4f l4 = GDN_L4(37, 4); const v4f l5 = GDN_L4(37, 5); __builtin_amdgcn_sched_barrier(0); x37 -= l0.x * x0; x37 -= l0.y * x1; x37 -= l0.z * x2; x37 -= l0.w * x3; x37 -= l1.x * x4; x37 -= l1.y * x5; x37 -= l1.z * x6; x37 -= l1.w * x7; x37 -= l2.x * x8; x37 -= l2.y * x9; x37 -= l2.z * x10; x37 -= l2.w * x11; x37 -= l3.x * x12; x37 -= l3.y * x13; x37 -= l3.z * x14; x37 -= l3.w * x15; x37 -= l4.x * x16; x37 -= l4.y * x17; x37 -= l4.z * x18; x37 -= l4.w * x19; x37 -= l5.x * x20; x37 -= l5.y * x21; x37 -= l5.z * x22; x37 -= l5.w * x23; } __builtin_amdgcn_sched_barrier(0); { const v4f l6 = GDN_L4(37, 6); const v4f l7 = GDN_L4(37, 7); const v4f l8 = GDN_L4(37, 8); const v4f l9 = GDN_L4(37, 9); __builtin_amdgcn_sched_barrier(0); x37 -= l6.x * x24; x37 -= l6.y * x25; x37 -= l6.z * x26; x37 -= l6.w * x27; x37 -= l7.x * x28; x37 -= l7.y * x29; x37 -= l7.z * x30; x37 -= l7.w * x31; x37 -= l8.x * x32; x37 -= l8.y * x33; x37 -= l8.z * x34; x37 -= l8.w * x35; x37 -= l9.x * x36; } __builtin_amdgcn_sched_barrier(0);
        float x38 = GDN_RHS(38); { const v4f l0 = GDN_L4(38, 0); const v4f l1 = GDN_L4(38, 1); const v4f l2 = GDN_L4(38, 2); const v4f l3 = GDN_L4(38, 3); const v4f l4 = GDN_L4(38, 4); const v4f l5 = GDN_L4(38, 5); __builtin_amdgcn_sched_barrier(0); x38 -= l0.x * x0; x38 -= l0.y * x1; x38 -= l0.z * x2; x38 -= l0.w * x3; x38 -= l1.x * x4; x38 -= l1.y * x5; x38 -= l1.z * x6; x38 -= l1.w * x7; x38 -= l2.x * x8; x38 -= l2.y * x9; x38 -= l2.z * x10; x38 -= l2.w * x11; x38 -= l3.x * x12; x38 -= l3.y * x13; x38 -= l3.z * x14; x38 -= l3.w * x15; x38 -= l4.x * x16; x38 -= l4.y * x17; x38 -= l4.z * x18; x38 -= l4.w * x19; x38 -= l5.x * x20; x38 -= l5.y * x21; x38 -= l5.z * x22; x38 -= l5.w * x23; } __builtin_amdgcn_sched_barrier(0); { const v4f l6 = GDN_L4(38, 6); const v4f l7 = GDN_L4(38, 7); const v4f l8 = GDN_L4(38, 8); const v4f l9 = GDN_L4(38, 9); __builtin_amdgcn_sched_barrier(0); x38 -= l6.x * x24; x38 -= l6.y * x25; x38 -= l6.z * x26; x38 -= l6.w * x27; x38 -= l7.x * x28; x38 -= l7.y * x29; x38 -= l7.z * x30; x38 -= l7.w * x31; x38 -= l8.x * x32; x38 -= l8.y * x33; x38 -= l8.z * x34; x38 -= l8.w * x35; x38 -= l9.x * x36; x38 -= l9.y * x37; } __builtin_amdgcn_sched_barrier(0);
        float x39 = GDN_RHS(39); { const v4f l0 = GDN_L4(39, 0); const v4f l1 = GDN_L4(39, 1); const v4f l2 = GDN_L4(39, 2); const v4f l3 = GDN_L4(39, 3); const v4f l4 = GDN_L4(39, 4); const v4f l5 = GDN_L4(39, 5); __builtin_amdgcn_sched_barrier(0); x39 -= l0.x * x0; x39 -= l0.y * x1; x39 -= l0.z * x2; x39 -= l0.w * x3; x39 -= l1.x * x4; x39 -= l1.y * x5; x39 -= l1.z * x6; x39 -= l1.w * x7; x39 -= l2.x * x8; x39 -= l2.y * x9; x39 -= l2.z * x10; x39 -= l2.w * x11; x39 -= l3.x * x12; x39 -= l3.y * x13; x39 -= l3.z * x14; x39 -= l3.w * x15; x39 -= l4.x * x16; x39 -= l4.y * x17; x39 -= l4.z * x18; x39 -= l4.w * x19; x39 -= l5.x * x20; x39 -= l5.y * x21; x39 -= l5.z * x22; x39 -= l5.w * x23; } __builtin_amdgcn_sched_barrier(0); { const v4f l6 = GDN_L4(39, 6); const v4f l7 = GDN_L4(39, 7); const v4f l8 = GDN_L4(39, 8); const v4f l9 = GDN_L4(39, 9); __builtin_amdgcn_sched_barrier(0); x39 -= l6.x * x24; x39 -= l6.y * x25; x39 -= l6.z * x26; x39 -= l6.w * x27; x39 -= l7.x * x28; x39 -= l7.y * x29; x39 -= l7.z * x30; x39 -= l7.w * x31; x39 -= l8.x * x32; x39 -= l8.y * x33; x39 -= l8.z * x34; x39 -= l8.w * x35; x39 -= l9.x * x36; x39 -= l9.y * x37; x39 -= l9.z * x38; } __builtin_amdgcn_sched_barrier(0);
        float x40 = GDN_RHS(40); { const v4f l0 = GDN_L4(40, 0); const v4f l1 = GDN_L4(40, 1); const v4f l2 = GDN_L4(40, 2); const v4f l3 = GDN_L4(40, 3); const v4f l4 = GDN_L4(40, 4); const v4f l5 = GDN_L4(40, 5); __builtin_amdgcn_sched_barrier(0); x40 -= l0.x * x0; x40 -= l0.y * x1; x40 -= l0.z * x2; x40 -= l0.w * x3; x40 -= l1.x * x4; x40 -= l1.y * x5; x40 -= l1.z * x6; x40 -= l1.w * x7; x40 -= l2.x * x8; x40 -= l2.y * x9; x40 -= l2.z * x10; x40 -= l2.w * x11; x40 -= l3.x * x12; x40 -= l3.y * x13; x40 -= l3.z * x14; x40 -= l3.w * x15; x40 -= l4.x * x16; x40 -= l4.y * x17; x40 -= l4.z * x18; x40 -= l4.w * x19; x40 -= l5.x * x20; x40 -= l5.y * x21; x40 -= l5.z * x22; x40 -= l5.w * x23; } __builtin_amdgcn_sched_barrier(0); { const v4f l6 = GDN_L4(40, 6); const v4f l7 = GDN_L4(40, 7); const v4f l8 = GDN_L4(40, 8); const v4f l9 = GDN_L4(40, 9); __builtin_amdgcn_sched_barrier(0); x40 -= l6.x * x24; x40 -= l6.y * x25; x40 -= l6.z * x26; x40 -= l6.w * x27; x40 -= l7.x * x28; x40 -= l7.y * x29; x40 -= l7.z * x30; x40 -= l7.w * x31; x40 -= l8.x * x32; x40 -= l8.y * x33; x40 -= l8.z * x34; x40 -= l8.w * x35; x40 -= l9.x * x36; x40 -= l9.y * x37; x40 -= l9.z * x38; x40 -= l9.w * x39; } __builtin_amdgcn_sched_barrier(0);
        float x41 = GDN_RHS(41); { const v4f l0 = GDN_L4(41, 0); const v4f l1 = GDN_L4(41, 1); const v4f l2 = GDN_L4(41, 2); const v4f l3 = GDN_L4(41, 3); const v4f l4 = GDN_L4(41, 4); const v4f l5 = GDN_L4(41, 5); __builtin_amdgcn_sched_barrier(0); x41 -= l0.x * x0; x41 -= l0.y * x1; x41 -= l0.z * x2; x41 -= l0.w * x3; x41 -= l1.x * x4; x41 -= l1.y * x5; x41 -= l1.z * x6; x41 -= l1.w * x7; x41 -= l2.x * x8; x41 -= l2.y * x9; x41 -= l2.z * x10; x41 -= l2.w * x11; x41 -= l3.x * x12; x41 -= l3.y * x13; x41 -= l3.z * x14; x41 -= l3.w * x15; x41 -= l4.x * x16; x41 -= l4.y * x17; x41 -= l4.z * x18; x41 -= l4.w * x19; x41 -= l5.x * x20; x41 -= l5.y * x21; x41 -= l5.z * x22; x41 -= l5.w * x23; } __builtin_amdgcn_sched_barrier(0); { const v4f l6 = GDN_L4(41, 6); const v4f l7 = GDN_L4(41, 7); const v4f l8 = GDN_L4(41, 8); const v4f l9 = GDN_L4(41, 9); const v4f l10 = GDN_L4(41, 10); __builtin_amdgcn_sched_barrier(0); x41 -= l6.x * x24; x41 -= l6.y * x25; x41 -= l6.z * x26; x41 -= l6.w * x27; x41 -= l7.x * x28; x41 -= l7.y * x29; x41 -= l7.z * x30; x41 -= l7.w * x31; x41 -= l8.x * x32; x41 -= l8.y * x33; x41 -= l8.z * x34; x41 -= l8.w * x35; x41 -= l9.x * x36; x41 -= l9.y * x37; x41 -= l9.z * x38; x41 -= l9.w * x39; x41 -= l10.x * x40; } __builtin_amdgcn_sched_barrier(0);
        float x42 = GDN_RHS(42); { const v4f l0 = GDN_L4(42, 0); const v4f l1 = GDN_L4(42, 1); const v4f l2 = GDN_L4(42, 2); const v4f l3 = GDN_L4(42, 3); const v4f l4 = GDN_L4(42, 4); const v4f l5 = GDN_L4(42, 5); __builtin_amdgcn_sched_barrier(0); x42 -= l0.x * x0; x42 -= l0.y * x1; x42 -= l0.z * x2; x42 -= l0.w * x3; x42 -= l1.x * x4; x42 -= l1.y * x5; x42 -= l1.z * x6; x42 -= l1.w * x7; x42 -= l2.x * x8; x42 -= l2.y * x9; x42 -= l2.z * x10; x42 -= l2.w * x11; x42 -= l3.x * x12; x42 -= l3.y * x13; x42 -= l3.z * x14; x42 -= l3.w * x15; x42 -= l4.x * x16; x42 -= l4.y * x17; x42 -= l4.z * x18; x42 -= l4.w * x19; x42 -= l5.x * x20; x42 -= l5.y * x21; x42 -= l5.z * x22; x42 -= l5.w * x23; } __builtin_amdgcn_sched_barrier(0); { const v4f l6 = GDN_L4(42, 6); const v4f l7 = GDN_L4(42, 7); const v4f l8 = GDN_L4(42, 8); const v4f l9 = GDN_L4(42, 9); const v4f l10 = GDN_L4(42, 10); __builtin_amdgcn_sched_barrier(0); x42 -= l6.x * x24; x42 -= l6.y * x25; x42 -= l6.z * x26; x42 -= l6.w * x27; x42 -= l7.x * x28; x42 -= l7.y * x29; x42 -= l7.z * x30; x42 -= l7.w * x31; x42 -= l8.x * x32; x42 -= l8.y * x33; x42 -= l8.z * x34; x42 -= l8.w * x35; x42 -= l9.x * x36; x42 -= l9.y * x37; x42 -= l9.z * x38; x42 -= l9.w * x39; x42 -= l10.x * x40; x42 -= l10.y * x41; } __builtin_amdgcn_sched_barrier(0);
        float x43 = GDN_RHS(43); { const v4f l0 = GDN_L4(43, 0); const v4f l1 = GDN_L4(43, 1); const v4f l2 = GDN_L4(43, 2); const v4f l3 = GDN_L4(43, 3); const v4f l4 = GDN_L4(43, 4); const v4f l5 = GDN_L4(43, 5); __builtin_amdgcn_sched_barrier(0); x43 -= l0.x * x0; x43 -= l0.y * x1; x43 -= l0.z * x2; x43 -= l0.w * x3; x43 -= l1.x * x4; x43 -= l1.y * x5; x43 -= l1.z * x6; x43 -= l1.w * x7; x43 -= l2.x * x8; x43 -= l2.y * x9; x43 -= l2.z * x10; x43 -= l2.w * x11; x43 -= l3.x * x12; x43 -= l3.y * x13; x43 -= l3.z * x14; x43 -= l3.w * x15; x43 -= l4.x * x16; x43 -= l4.y * x17; x43 -= l4.z * x18; x43 -= l4.w * x19; x43 -= l5.x * x20; x43 -= l5.y * x21; x43 -= l5.z * x22; x43 -= l5.w * x23; } __builtin_amdgcn_sched_barrier(0); { const v4f l6 = GDN_L4(43, 6); const v4f l7 = GDN_L4(43, 7); const v4f l8 = GDN_L4(43, 8); const v4f l9 = GDN_L4(43, 9); const v4f l10 = GDN_L4(43, 10); __builtin_amdgcn_sched_barrier(0); x43 -= l6.x * x24; x43 -= l6.y * x25; x43 -= l6.z * x26; x43 -= l6.w * x27; x43 -= l7.x * x28; x43 -= l7.y * x29; x43 -= l7.z * x30; x43 -= l7.w * x31; x43 -= l8.x * x32; x43 -= l8.y * x33; x43 -= l8.z * x34; x43 -= l8.w * x35; x43 -= l9.x * x36; x43 -= l9.y * x37; x43 -= l9.z * x38; x43 -= l9.w * x39; x43 -= l10.x * x40; x43 -= l10.y * x41; x43 -= l10.z * x42; } __builtin_amdgcn_sched_barrier(0);
        float x44 = GDN_RHS(44); { const v4f l0 = GDN_L4(44, 0); const v4f l1 = GDN_L4(44, 1); const v4f l2 = GDN_L4(44, 2); const v4f l3 = GDN_L4(44, 3); const v4f l4 = GDN_L4(44, 4); const v4f l5 = GDN_L4(44, 5); __builtin_amdgcn_sched_barrier(0); x44 -= l0.x * x0; x44 -= l0.y * x1; x44 -= l0.z * x2; x44 -= l0.w * x3; x44 -= l1.x * x4; x44 -= l1.y * x5; x44 -= l1.z * x6; x44 -= l1.w * x7; x44 -= l2.x * x8; x44 -= l2.y * x9; x44 -= l2.z * x10; x44 -= l2.w * x11; x44 -= l3.x * x12; x44 -= l3.y * x13; x44 -= l3.z * x14; x44 -= l3.w * x15; x44 -= l4.x * x16; x44 -= l4.y * x17; x44 -= l4.z * x18; x44 -= l4.w * x19; x44 -= l5.x * x20; x44 -= l5.y * x21; x44 -= l5.z * x22; x44 -= l5.w * x23; } __builtin_amdgcn_sched_barrier(0); { const v4f l6 = GDN_L4(44, 6); const v4f l7 = GDN_L4(44, 7); const v4f l8 = GDN_L4(44, 8); const v4f l9 = GDN_L4(44, 9); const v4f l10 = GDN_L4(44, 10); __builtin_amdgcn_sched_barrier(0); x44 -= l6.x * x24; x44 -= l6.y * x25; x44 -= l6.z * x26; x44 -= l6.w * x27; x44 -= l7.x * x28; x44 -= l7.y * x29; x44 -= l7.z * x30; x44 -= l7.w * x31; x44 -= l8.x * x32; x44 -= l8.y * x33; x44 -= l8.z * x34; x44 -= l8.w * x35; x44 -= l9.x * x36; x44 -= l9.y * x37; x44 -= l9.z * x38; x44 -= l9.w * x39; x44 -= l10.x * x40; x44 -= l10.y * x41; x44 -= l10.z * x42; x44 -= l10.w * x43; } __builtin_amdgcn_sched_barrier(0);
        float x45 = GDN_RHS(45); { const v4f l0 = GDN_L4(45, 0); const v4f l1 = GDN_L4(45, 1); const v4f l2 = GDN_L4(45, 2); const v4f l3 = GDN_L4(45, 3); const v4f l4 = GDN_L4(45, 4); const v4f l5 = GDN_L4(45, 5); __builtin_amdgcn_sched_barrier(0); x45 -= l0.x * x0; x45 -= l0.y * x1; x45 -= l0.z * x2; x45 -= l0.w * x3; x45 -= l1.x * x4; x45 -= l1.y * x5; x45 -= l1.z * x6; x45 -= l1.w * x7; x45 -= l2.x * x8; x45 -= l2.y * x9; x45 -= l2.z * x10; x45 -= l2.w * x11; x45 -= l3.x * x12; x45 -= l3.y * x13; x45 -= l3.z * x14; x45 -= l3.w * x15; x45 -= l4.x * x16; x45 -= l4.y * x17; x45 -= l4.z * x18; x45 -= l4.w * x19; x45 -= l5.x * x20; x45 -= l5.y * x21; x45 -= l5.z * x22; x45 -= l5.w * x23; } __builtin_amdgcn_sched_barrier(0); { const v4f l6 = GDN_L4(45, 6); const v4f l7 = GDN_L4(45, 7); const v4f l8 = GDN_L4(45, 8); const v4f l9 = GDN_L4(45, 9); const v4f l10 = GDN_L4(45, 10); const v4f l11 = GDN_L4(45, 11); __builtin_amdgcn_sched_barrier(0); x45 -= l6.x * x24; x45 -= l6.y * x25; x45 -= l6.z * x26; x45 -= l6.w * x27; x45 -= l7.x * x28; x45 -= l7.y * x29; x45 -= l7.z * x30; x45 -= l7.w * x31; x45 -= l8.x * x32; x45 -= l8.y * x33; x45 -= l8.z * x34; x45 -= l8.w * x35; x45 -= l9.x * x36; x45 -= l9.y * x37; x45 -= l9.z * x38; x45 -= l9.w * x39; x45 -= l10.x * x40; x45 -= l10.y * x41; x45 -= l10.z * x42; x45 -= l10.w * x43; x45 -= l11.x * x44; } __builtin_amdgcn_sched_barrier(0);
        float x46 = GDN_RHS(46); { const v4f l0 = GDN_L4(46, 0); const v4f l1 = GDN_L4(46, 1); const v4f l2 = GDN_L4(46, 2); const v4f l3 = GDN_L4(46, 3); const v4f l4 = GDN_L4(46, 4); const v4f l5 = GDN_L4(46, 5); __builtin_amdgcn_sched_barrier(0); x46 -= l0.x * x0; x46 -= l0.y * x1; x46 -= l0.z * x2; x46 -= l0.w * x3; x46 -= l1.x * x4; x46 -= l1.y * x5; x46 -= l1.z * x6; x46 -= l1.w * x7; x46 -= l2.x * x8; x46 -= l2.y * x9; x46 -= l2.z * x10; x46 -= l2.w * x11; x46 -= l3.x * x12; x46 -= l3.y * x13; x46 -= l3.z * x14; x46 -= l3.w * x15; x46 -= l4.x * x16; x46 -= l4.y * x17; x46 -= l4.z * x18; x46 -= l4.w * x19; x46 -= l5.x * x20; x46 -= l5.y * x21; x46 -= l5.z * x22; x46 -= l5.w * x23; } __builtin_amdgcn_sched_barrier(0); { const v4f l6 = GDN_L4(46, 6); const v4f l7 = GDN_L4(46, 7); const v4f l8 = GDN_L4(46, 8); const v4f l9 = GDN_L4(46, 9); const v4f l10 = GDN_L4(46, 10); const v4f l11 = GDN_L4(46, 11); __builtin_amdgcn_sched_barrier(0); x46 -= l6.x * x24; x46 -= l6.y * x25; x46 -= l6.z * x26; x46 -= l6.w * x27; x46 -= l7.x * x28; x46 -= l7.y * x29; x46 -= l7.z * x30; x46 -= l7.w * x31; x46 -= l8.x * x32; x46 -= l8.y * x33; x46 -= l8.z * x34; x46 -= l8.w * x35; x46 -= l9.x * x36; x46 -= l9.y * x37; x46 -= l9.z * x38; x46 -= l9.w * x39; x46 -= l10.x * x40; x46 -= l10.y * x41; x46 -= l10.z * x42; x46 -= l10.w * x43; x46 -= l11.x * x44; x46 -= l11.y * x45; } __builtin_amdgcn_sched_barrier(0);
        float x47 = GDN_RHS(47); { const v4f l0 = GDN_L4(47, 0); const v4f l1 = GDN_L4(47, 1); const v4f l2 = GDN_L4(47, 2); const v4f l3 = GDN_L4(47, 3); const v4f l4 = GDN_L4(47, 4); const v4f l5 = GDN_L4(47, 5); __builtin_amdgcn_sched_barrier(0); x47 -= l0.x * x0; x47 -= l0.y * x1; x47 -= l0.z * x2; x47 -= l0.w * x3; x47 -= l1.x * x4; x47 -= l1.y * x5; x47 -= l1.z * x6; x47 -= l1.w * x7; x47 -= l2.x * x8; x47 -= l2.y * x9; x47 -= l2.z * x10; x47 -= l2.w * x11; x47 -= l3.x * x12; x47 -= l3.y * x13; x47 -= l3.z * x14; x47 -= l3.w * x15; x47 -= l4.x * x16; x47 -= l4.y * x17; x47 -= l4.z * x18; x47 -= l4.w * x19; x47 -= l5.x * x20; x47 -= l5.y * x21; x47 -= l5.z * x22; x47 -= l5.w * x23; } __builtin_amdgcn_sched_barrier(0); { const v4f l6 = GDN_L4(47, 6); const v4f l7 = GDN_L4(47, 7); const v4f l8 = GDN_L4(47, 8); const v4f l9 = GDN_L4(47, 9); const v4f l10 = GDN_L4(47, 10); const v4f l11 = GDN_L4(47, 11); __builtin_amdgcn_sched_barrier(0); x47 -= l6.x * x24; x47 -= l6.y * x25; x47 -= l6.z * x26; x47 -= l6.w * x27; x47 -= l7.x * x28; x47 -= l7.y * x29; x47 -= l7.z * x30; x47 -= l7.w * x31; x47 -= l8.x * x32; x47 -= l8.y * x33; x47 -= l8.z * x34; x47 -= l8.w * x35; x47 -= l9.x * x36; x47 -= l9.y * x37; x47 -= l9.z * x38; x47 -= l9.w * x39; x47 -= l10.x * x40; x47 -= l10.y * x41; x47 -= l10.z * x42; x47 -= l10.w * x43; x47 -= l11.x * x44; x47 -= l11.y * x45; x47 -= l11.z * x46; } __builtin_amdgcn_sched_barrier(0);
        float x48 = GDN_RHS(48); { const v4f l0 = GDN_L4(48, 0); const v4f l1 = GDN_L4(48, 1); const v4f l2 = GDN_L4(48, 2); const v4f l3 = GDN_L4(48, 3); const v4f l4 = GDN_L4(48, 4); const v4f l5 = GDN_L4(48, 5); __builtin_amdgcn_sched_barrier(0); x48 -= l0.x * x0; x48 -= l0.y * x1; x48 -= l0.z * x2; x48 -= l0.w * x3; x48 -= l1.x * x4; x48 -= l1.y * x5; x48 -= l1.z * x6; x48 -= l1.w * x7; x48 -= l2.x * x8; x48 -= l2.y * x9; x48 -= l2.z * x10; x48 -= l2.w * x11; x48 -= l3.x * x12; x48 -= l3.y * x13; x48 -= l3.z * x14; x48 -= l3.w * x15; x48 -= l4.x * x16; x48 -= l4.y * x17; x48 -= l4.z * x18; x48 -= l4.w * x19; x48 -= l5.x * x20; x48 -= l5.y * x21; x48 -= l5.z * x22; x48 -= l5.w * x23; } __builtin_amdgcn_sched_barrier(0); { const v4f l6 = GDN_L4(48, 6); const v4f l7 = GDN_L4(48, 7); const v4f l8 = GDN_L4(48, 8); const v4f l9 = GDN_L4(48, 9); const v4f l10 = GDN_L4(48, 10); const v4f l11 = GDN_L4(48, 11); __builtin_amdgcn_sched_barrier(0); x48 -= l6.x * x24; x48 -= l6.y * x25; x48 -= l6.z * x26; x48 -= l6.w * x27; x48 -= l7.x * x28; x48 -= l7.y * x29; x48 -= l7.z * x30; x48 -= l7.w * x31; x48 -= l8.x * x32; x48 -= l8.y * x33; x48 -= l8.z * x34; x48 -= l8.w * x35; x48 -= l9.x * x36; x48 -= l9.y * x37; x48 -= l9.z * x38; x48 -= l9.w * x39; x48 -= l10.x * x40; x48 -= l10.y * x41; x48 -= l10.z * x42; x48 -= l10.w * x43; x48 -= l11.x * x44; x48 -= l11.y * x45; x48 -= l11.z * x46; x48 -= l11.w * x47; } __builtin_amdgcn_sched_barrier(0);
        float x49 = GDN_RHS(49); { const v4f l0 = GDN_L4(49, 0); const v4f l1 = GDN_L4(49, 1); const v4f l2 = GDN_L4(49, 2); const v4f l3 = GDN_L4(49, 3); const v4f l4 = GDN_L4(49, 4); const v4f l5 = GDN_L4(49, 5); __builtin_amdgcn_sched_barrier(0); x49 -= l0.x * x0; x49 -= l0.y * x1; x49 -= l0.z * x2; x49 -= l0.w * x3; x49 -= l1.x * x4; x49 -= l1.y * x5; x49 -= l1.z * x6; x49 -= l1.w * x7; x49 -= l2.x * x8; x49 -= l2.y * x9; x49 -= l2.z * x10; x49 -= l2.w * x11; x49 -= l3.x * x12; x49 -= l3.y * x13; x49 -= l3.z * x14; x49 -= l3.w * x15; x49 -= l4.x * x16; x49 -= l4.y * x17; x49 -= l4.z * x18; x49 -= l4.w * x19; x49 -= l5.x * x20; x49 -= l5.y * x21; x49 -= l5.z * x22; x49 -= l5.w * x23; } __builtin_amdgcn_sched_barrier(0); { const v4f l6 = GDN_L4(49, 6); const v4f l7 = GDN_L4(49, 7); const v4f l8 = GDN_L4(49, 8); const v4f l9 = GDN_L4(49, 9); const v4f l10 = GDN_L4(49, 10); const v4f l11 = GDN_L4(49, 11); __builtin_amdgcn_sched_barrier(0); x49 -= l6.x * x24; x49 -= l6.y * x25; x49 -= l6.z * x26; x49 -= l6.w * x27; x49 -= l7.x * x28; x49 -= l7.y * x29; x49 -= l7.z * x30; x49 -= l7.w * x31; x49 -= l8.x * x32; x49 -= l8.y * x33; x49 -= l8.z * x34; x49 -= l8.w * x35; x49 -= l9.x * x36; x49 -= l9.y * x37; x49 -= l9.z * x38; x49 -= l9.w * x39; x49 -= l10.x * x40; x49 -= l10.y * x41; x49 -= l10.z * x42; x49 -= l10.w * x43; x49 -= l11.x * x44; x49 -= l11.y * x45; x49 -= l11.z * x46; x49 -= l11.w * x47; } __builtin_amdgcn_sched_barrier(0); { const v4f l12 = GDN_L4(49, 12); __builtin_amdgcn_sched_barrier(0); x49 -= l12.x * x48; } __builtin_amdgcn_sched_barrier(0);
        float x50 = GDN_RHS(50); { const v4f l0 = GDN_L4(50, 0); const v4f l1 = GDN_L4(50, 1); const v4f l2 = GDN_L4(50, 2); const v4f l3 = GDN_L4(50, 3); const v4f l4 = GDN_L4(50, 4); const v4f l5 = GDN_L4(50, 5); __builtin_amdgcn_sched_barrier(0); x50 -= l0.x * x0; x50 -= l0.y * x1; x50 -= l0.z * x2; x50 -= l0.w * x3; x50 -= l1.x * x4; x50 -= l1.y * x5; x50 -= l1.z * x6; x50 -= l1.w * x7; x50 -= l2.x * x8; x50 -= l2.y * x9; x50 -= l2.z * x10; x50 -= l2.w * x11; x50 -= l3.x * x12; x50 -= l3.y * x13; x50 -= l3.z * x14; x50 -= l3.w * x15; x50 -= l4.x * x16; x50 -= l4.y * x17; x50 -= l4.z * x18; x50 -= l4.w * x19; x50 -= l5.x * x20; x50 -= l5.y * x21; x50 -= l5.z * x22; x50 -= l5.w * x23; } __builtin_amdgcn_sched_barrier(0); { const v4f l6 = GDN_L4(50, 6); const v4f l7 = GDN_L4(50, 7); const v4f l8 = GDN_L4(50, 8); const v4f l9 = GDN_L4(50, 9); const v4f l10 = GDN_L4(50, 10); const v4f l11 = GDN_L4(50, 11); __builtin_amdgcn_sched_barrier(0); x50 -= l6.x * x24; x50 -= l6.y * x25; x50 -= l6.z * x26; x50 -= l6.w * x27; x50 -= l7.x * x28; x50 -= l7.y * x29; x50 -= l7.z * x30; x50 -= l7.w * x31; x50 -= l8.x * x32; x50 -= l8.y * x33; x50 -= l8.z * x34; x50 -= l8.w * x35; x50 -= l9.x * x36; x50 -= l9.y * x37; x50 -= l9.z * x38; x50 -= l9.w * x39; x50 -= l10.x * x40; x50 -= l10.y * x41; x50 -= l10.z * x42; x50 -= l10.w * x43; x50 -= l11.x * x44; x50 -= l11.y * x45; x50 -= l11.z * x46; x50 -= l11.w * x47; } __builtin_amdgcn_sched_barrier(0); { const v4f l12 = GDN_L4(50, 12); __builtin_amdgcn_sched_barrier(0); x50 -= l12.x * x48; x50 -= l12.y * x49; } __builtin_amdgcn_sched_barrier(0);
        float x51 = GDN_RHS(51); { const v4f l0 = GDN_L4(51, 0); const v4f l1 = GDN_L4(51, 1); const v4f l2 = GDN_L4(51, 2); const v4f l3 = GDN_L4(51, 3); const v4f l4 = GDN_L4(51, 4); const v4f l5 = GDN_L4(51, 5); __builtin_amdgcn_sched_barrier(0); x51 -= l0.x * x0; x51 -= l0.y * x1; x51 -= l0.z * x2; x51 -= l0.w * x3; x51 -= l1.x * x4; x51 -= l1.y * x5; x51 -= l1.z * x6; x51 -= l1.w * x7; x51 -= l2.x * x8; x51 -= l2.y * x9; x51 -= l2.z * x10; x51 -= l2.w * x11; x51 -= l3.x * x12; x51 -= l3.y * x13; x51 -= l3.z * x14; x51 -= l3.w * x15; x51 -= l4.x * x16; x51 -= l4.y * x17; x51 -= l4.z * x18; x51 -= l4.w * x19; x51 -= l5.x * x20; x51 -= l5.y * x21; x51 -= l5.z * x22; x51 -= l5.w * x23; } __builtin_amdgcn_sched_barrier(0); { const v4f l6 = GDN_L4(51, 6); const v4f l7 = GDN_L4(51, 7); const v4f l8 = GDN_L4(51, 8); const v4f l9 = GDN_L4(51, 9); const v4f l10 = GDN_L4(51, 10); const v4f l11 = GDN_L4(51, 11); __builtin_amdgcn_sched_barrier(0); x51 -= l6.x * x24; x51 -= l6.y * x25; x51 -= l6.z * x26; x51 -= l6.w * x27; x51 -= l7.x * x28; x51 -= l7.y * x29; x51 -= l7.z * x30; x51 -= l7.w * x31; x51 -= l8.x * x32; x51 -= l8.y * x33; x51 -= l8.z * x34; x51 -= l8.w * x35; x51 -= l9.x * x36; x51 -= l9.y * x37; x51 -= l9.z * x38; x51 -= l9.w * x39; x51 -= l10.x * x40; x51 -= l10.y * x41; x51 -= l10.z * x42; x51 -= l10.w * x43; x51 -= l11.x * x44; x51 -= l11.y * x45; x51 -= l11.z * x46; x51 -= l11.w * x47; } __builtin_amdgcn_sched_barrier(0); { const v4f l12 = GDN_L4(51, 12); __builtin_amdgcn_sched_barrier(0); x51 -= l12.x * x48; x51 -= l12.y * x49; x51 -= l12.z * x50; } __builtin_amdgcn_sched_barrier(0);
        float x52 = GDN_RHS(52); { const v4f l0 = GDN_L4(52, 0); const v4f l1 = GDN_L4(52, 1); const v4f l2 = GDN_L4(52, 2); const v4f l3 = GDN_L4(52, 3); const v4f l4 = GDN_L4(52, 4); const v4f l5 = GDN_L4(52, 5); __builtin_amdgcn_sched_barrier(0); x52 -= l0.x * x0; x52 -= l0.y * x1; x52 -= l0.z * x2; x52 -= l0.w * x3; x52 -= l1.x * x4; x52 -= l1.y * x5; x52 -= l1.z * x6; x52 -= l1.w * x7; x52 -= l2.x * x8; x52 -= l2.y * x9; x52 -= l2.z * x10; x52 -= l2.w * x11; x52 -= l3.x * x12; x52 -= l3.y * x13; x52 -= l3.z * x14; x52 -= l3.w * x15; x52 -= l4.x * x16; x52 -= l4.y * x17; x52 -= l4.z * x18; x52 -= l4.w * x19; x52 -= l5.x * x20; x52 -= l5.y * x21; x52 -= l5.z * x22; x52 -= l5.w * x23; } __builtin_amdgcn_sched_barrier(0); { const v4f l6 = GDN_L4(52, 6); const v4f l7 = GDN_L4(52, 7); const v4f l8 = GDN_L4(52, 8); const v4f l9 = GDN_L4(52, 9); const v4f l10 = GDN_L4(52, 10); const v4f l11 = GDN_L4(52, 11); __builtin_amdgcn_sched_barrier(0); x52 -= l6.x * x24; x52 -= l6.y * x25; x52 -= l6.z * x26; x52 -= l6.w * x27; x52 -= l7.x * x28; x52 -= l7.y * x29; x52 -= l7.z * x30; x52 -= l7.w * x31; x52 -= l8.x * x32; x52 -= l8.y * x33; x52 -= l8.z * x34; x52 -= l8.w * x35; x52 -= l9.x * x36; x52 -= l9.y * x37; x52 -= l9.z * x38; x52 -= l9.w * x39; x52 -= l10.x * x40; x52 -= l10.y * x41; x52 -= l10.z * x42; x52 -= l10.w * x43; x52 -= l11.x * x44; x52 -= l11.y * x45; x52 -= l11.z * x46; x52 -= l11.w * x47; } __builtin_amdgcn_sched_barrier(0); { const v4f l12 = GDN_L4(52, 12); __builtin_amdgcn_sched_barrier(0); x52 -= l12.x * x48; x52 -= l12.y * x49; x52 -= l12.z * x50; x52 -= l12.w * x51; } __builtin_amdgcn_sched_barrier(0);
        float x53 = GDN_RHS(53); { const v4f l0 = GDN_L4(53, 0); const v4f l1 = GDN_L4(53, 1); const v4f l2 = GDN_L4(53, 2); const v4f l3 = GDN_L4(53, 3); const v4f l4 = GDN_L4(53, 4); const v4f l5 = GDN_L4(53, 5); __builtin_amdgcn_sched_barrier(0); x53 -= l0.x * x0; x53 -= l0.y * x1; x53 -= l0.z * x2; x53 -= l0.w * x3; x53 -= l1.x * x4; x53 -= l1.y * x5; x53 -= l1.z * x6; x53 -= l1.w * x7; x53 -= l2.x * x8; x53 -= l2.y * x9; x53 -= l2.z * x10; x53 -= l2.w * x11; x53 -= l3.x * x12; x53 -= l3.y * x13; x53 -= l3.z * x14; x53 -= l3.w * x15; x53 -= l4.x * x16; x53 -= l4.y * x17; x53 -= l4.z * x18; x53 -= l4.w * x19; x53 -= l5.x * x20; x53 -= l5.y * x21; x53 -= l5.z * x22; x53 -= l5.w * x23; } __builtin_amdgcn_sched_barrier(0); { const v4f l6 = GDN_L4(53, 6); const v4f l7 = GDN_L4(53, 7); const v4f l8 = GDN_L4(53, 8); const v4f l9 = GDN_L4(53, 9); const v4f l10 = GDN_L4(53, 10); const v4f l11 = GDN_L4(53, 11); __builtin_amdgcn_sched_barrier(0); x53 -= l6.x * x24; x53 -= l6.y * x25; x53 -= l6.z * x26; x53 -= l6.w * x27; x53 -= l7.x * x28; x53 -= l7.y * x29; x53 -= l7.z * x30; x53 -= l7.w * x31; x53 -= l8.x * x32; x53 -= l8.y * x33; x53 -= l8.z * x34; x53 -= l8.w * x35; x53 -= l9.x * x36; x53 -= l9.y * x37; x53 -= l9.z * x38; x53 -= l9.w * x39; x53 -= l10.x * x40; x53 -= l10.y * x41; x53 -= l10.z * x42; x53 -= l10.w * x43; x53 -= l11.x * x44; x53 -= l11.y * x45; x53 -= l11.z * x46; x53 -= l11.w * x47; } __builtin_amdgcn_sched_barrier(0); { const v4f l12 = GDN_L4(53, 12); const v4f l13 = GDN_L4(53, 13); __builtin_amdgcn_sched_barrier(0); x53 -= l12.x * x48; x53 -= l12.y * x49; x53 -= l12.z * x50; x53 -= l12.w * x51; x53 -= l13.x * x52; } __builtin_amdgcn_sched_barrier(0);
        float x54 = GDN_RHS(54); { const v4f l0 = GDN_L4(54, 0); const v4f l1 = GDN_L4(54, 1); const v4f l2 = GDN_L4(54, 2); const v4f l3 = GDN_L4(54, 3); const v4f l4 = GDN_L4(54, 4); const v4f l5 = GDN_L4(54, 5); __builtin_amdgcn_sched_barrier(0); x54 -= l0.x * x0; x54 -= l0.y * x1; x54 -= l0.z * x2; x54 -= l0.w * x3; x54 -= l1.x * x4; x54 -= l1.y * x5; x54 -= l1.z * x6; x54 -= l1.w * x7; x54 -= l2.x * x8; x54 -= l2.y * x9; x54 -= l2.z * x10; x54 -= l2.w * x11; x54 -= l3.x * x12; x54 -= l3.y * x13; x54 -= l3.z * x14; x54 -= l3.w * x15; x54 -= l4.x * x16; x54 -= l4.y * x17; x54 -= l4.z * x18; x54 -= l4.w * x19; x54 -= l5.x * x20; x54 -= l5.y * x21; x54 -= l5.z * x22; x54 -= l5.w * x23; } __builtin_amdgcn_sched_barrier(0); { const v4f l6 = GDN_L4(54, 6); const v4f l7 = GDN_L4(54, 7); const v4f l8 = GDN_L4(54, 8); const v4f l9 = GDN_L4(54, 9); const v4f l10 = GDN_L4(54, 10); const v4f l11 = GDN_L4(54, 11); __builtin_amdgcn_sched_barrier(0); x54 -= l6.x * x24; x54 -= l6.y * x25; x54 -= l6.z * x26; x54 -= l6.w * x27; x54 -= l7.x * x28; x54 -= l7.y * x29; x54 -= l7.z * x30; x54 -= l7.w * x31; x54 -= l8.x * x32; x54 -= l8.y * x33; x54 -= l8.z * x34; x54 -= l8.w * x35; x54 -= l9.x * x36; x54 -= l9.y * x37; x54 -= l9.z * x38; x54 -= l9.w * x39; x54 -= l10.x * x40; x54 -= l10.y * x41; x54 -= l10.z * x42; x54 -= l10.w * x43; x54 -= l11.x * x44; x54 -= l11.y * x45; x54 -= l11.z * x46; x54 -= l11.w * x47; } __builtin_amdgcn_sched_barrier(0); { const v4f l12 = GDN_L4(54, 12); const v4f l13 = GDN_L4(54, 13); __builtin_amdgcn_sched_barrier(0); x54 -= l12.x * x48; x54 -= l12.y * x49; x54 -= l12.z * x50; x54 -= l12.w * x51; x54 -= l13.x * x52; x54 -= l13.y * x53; } __builtin_amdgcn_sched_barrier(0);
        float x55 = GDN_RHS(55); { const v4f l0 = GDN_L4(55, 0); const v4f l1 = GDN_L4(55, 1); const v4f l2 = GDN_L4(55, 2); const v4f l3 = GDN_L4(55, 3); const v4f l4 = GDN_L4(55, 4); const v4f l5 = GDN_L4(55, 5); __builtin_amdgcn_sched_barrier(0); x55 -= l0.x * x0; x55 -= l0.y * x1; x55 -= l0.z * x2; x55 -= l0.w * x3; x55 -= l1.x * x4; x55 -= l1.y * x5; x55 -= l1.z * x6; x55 -= l1.w * x7; x55 -= l2.x * x8; x55 -= l2.y * x9; x55 -= l2.z * x10; x55 -= l2.w * x11; x55 -= l3.x * x12; x55 -= l3.y * x13; x55 -= l3.z * x14; x55 -= l3.w * x15; x55 -= l4.x * x16; x55 -= l4.y * x17; x55 -= l4.z * x18; x55 -= l4.w * x19; x55 -= l5.x * x20; x55 -= l5.y * x21; x55 -= l5.z * x22; x55 -= l5.w * x23; } __builtin_amdgcn_sched_barrier(0); { const v4f l6 = GDN_L4(55, 6); const v4f l7 = GDN_L4(55, 7); const v4f l8 = GDN_L4(55, 8); const v4f l9 = GDN_L4(55, 9); const v4f l10 = GDN_L4(55, 10); const v4f l11 = GDN_L4(55, 11); __builtin_amdgcn_sched_barrier(0); x55 -= l6.x * x24; x55 -= l6.y * x25; x55 -= l6.z * x26; x55 -= l6.w * x27; x55 -= l7.x * x28; x55 -= l7.y * x29; x55 -= l7.z * x30; x55 -= l7.w * x31; x55 -= l8.x * x32; x55 -= l8.y * x33; x55 -= l8.z * x34; x55 -= l8.w * x35; x55 -= l9.x * x36; x55 -= l9.y * x37; x55 -= l9.z * x38; x55 -= l9.w * x39; x55 -= l10.x * x40; x55 -= l10.y * x41; x55 -= l10.z * x42; x55 -= l10.w * x43; x55 -= l11.x * x44; x55 -= l11.y * x45; x55 -= l11.z * x46; x55 -= l11.w * x47; } __builtin_amdgcn_sched_barrier(0); { const v4f l12 = GDN_L4(55, 12); const v4f l13 = GDN_L4(55, 13); __builtin_amdgcn_sched_barrier(0); x55 -= l12.x * x48; x55 -= l12.y * x49; x55 -= l12.z * x50; x55 -= l12.w * x51; x55 -= l13.x * x52; x55 -= l13.y * x53; x55 -= l13.z * x54; } __builtin_amdgcn_sched_barrier(0);
        float x56 = GDN_RHS(56); { const v4f l0 = GDN_L4(56, 0); const v4f l1 = GDN_L4(56, 1); const v4f l2 = GDN_L4(56, 2); const v4f l3 = GDN_L4(56, 3); const v4f l4 = GDN_L4(56, 4); const v4f l5 = GDN_L4(56, 5); __builtin_amdgcn_sched_barrier(0); x56 -= l0.x * x0; x56 -= l0.y * x1; x56 -= l0.z * x2; x56 -= l0.w * x3; x56 -= l1.x * x4; x56 -= l1.y * x5; x56 -= l1.z * x6; x56 -= l1.w * x7; x56 -= l2.x * x8; x56 -= l2.y * x9; x56 -= l2.z * x10; x56 -= l2.w * x11; x56 -= l3.x * x12; x56 -= l3.y * x13; x56 -= l3.z * x14; x56 -= l3.w * x15; x56 -= l4.x * x16; x56 -= l4.y * x17; x56 -= l4.z * x18; x56 -= l4.w * x19; x56 -= l5.x * x20; x56 -= l5.y * x21; x56 -= l5.z * x22; x56 -= l5.w * x23; } __builtin_amdgcn_sched_barrier(0); { const v4f l6 = GDN_L4(56, 6); const v4f l7 = GDN_L4(56, 7); const v4f l8 = GDN_L4(56, 8); const v4f l9 = GDN_L4(56, 9); const v4f l10 = GDN_L4(56, 10); const v4f l11 = GDN_L4(56, 11); __builtin_amdgcn_sched_barrier(0); x56 -= l6.x * x24; x56 -= l6.y * x25; x56 -= l6.z * x26; x56 -= l6.w * x27; x56 -= l7.x * x28; x56 -= l7.y * x29; x56 -= l7.z * x30; x56 -= l7.w * x31; x56 -= l8.x * x32; x56 -= l8.y * x33; x56 -= l8.z * x34; x56 -= l8.w * x35; x56 -= l9.x * x36; x56 -= l9.y * x37; x56 -= l9.z * x38; x56 -= l9.w * x39; x56 -= l10.x * x40; x56 -= l10.y * x41; x56 -= l10.z * x42; x56 -= l10.w * x43; x56 -= l11.x * x44; x56 -= l11.y * x45; x56 -= l11.z * x46; x56 -= l11.w * x47; } __builtin_amdgcn_sched_barrier(0); { const v4f l12 = GDN_L4(56, 12); const v4f l13 = GDN_L4(56, 13); __builtin_amdgcn_sched_barrier(0); x56 -= l12.x * x48; x56 -= l12.y * x49; x56 -= l12.z * x50; x56 -= l12.w * x51; x56 -= l13.x * x52; x56 -= l13.y * x53; x56 -= l13.z * x54; x56 -= l13.w * x55; } __builtin_amdgcn_sched_barrier(0);
        float x57 = GDN_RHS(57); { const v4f l0 = GDN_L4(57, 0); const v4f l1 = GDN_L4(57, 1); const v4f l2 = GDN_L4(57, 2); const v4f l3 = GDN_L4(57, 3); const v4f l4 = GDN_L4(57, 4); const v4f l5 = GDN_L4(57, 5); __builtin_amdgcn_sched_barrier(0); x57 -= l0.x * x0; x57 -= l0.y * x1; x57 -= l0.z * x2; x57 -= l0.w * x3; x57 -= l1.x * x4; x57 -= l1.y * x5; x57 -= l1.z * x6; x57 -= l1.w * x7; x57 -= l2.x * x8; x57 -= l2.y * x9; x57 -= l2.z * x10; x57 -= l2.w * x11; x57 -= l3.x * x12; x57 -= l3.y * x13; x57 -= l3.z * x14; x57 -= l3.w * x15; x57 -= l4.x * x16; x57 -= l4.y * x17; x57 -= l4.z * x18; x57 -= l4.w * x19; x57 -= l5.x * x20; x57 -= l5.y * x21; x57 -= l5.z * x22; x57 -= l5.w * x23; } __builtin_amdgcn_sched_barrier(0); { const v4f l6 = GDN_L4(57, 6); const v4f l7 = GDN_L4(57, 7); const v4f l8 = GDN_L4(57, 8); const v4f l9 = GDN_L4(57, 9); const v4f l10 = GDN_L4(57, 10); const v4f l11 = GDN_L4(57, 11); __builtin_amdgcn_sched_barrier(0); x57 -= l6.x * x24; x57 -= l6.y * x25; x57 -= l6.z * x26; x57 -= l6.w * x27; x57 -= l7.x * x28; x57 -= l7.y * x29; x57 -= l7.z * x30; x57 -= l7.w * x31; x57 -= l8.x * x32; x57 -= l8.y * x33; x57 -= l8.z * x34; x57 -= l8.w * x35; x57 -= l9.x * x36; x57 -= l9.y * x37; x57 -= l9.z * x38; x57 -= l9.w * x39; x57 -= l10.x * x40; x57 -= l10.y * x41; x57 -= l10.z * x42; x57 -= l10.w * x43; x57 -= l11.x * x44; x57 -= l11.y * x45; x57 -= l11.z * x46; x57 -= l11.w * x47; } __builtin_amdgcn_sched_barrier(0); { const v4f l12 = GDN_L4(57, 12); const v4f l13 = GDN_L4(57, 13); const v4f l14 = GDN_L4(57, 14); __builtin_amdgcn_sched_barrier(0); x57 -= l12.x * x48; x57 -= l12.y * x49; x57 -= l12.z * x50; x57 -= l12.w * x51; x57 -= l13.x * x52; x57 -= l13.y * x53; x57 -= l13.z * x54; x57 -= l13.w * x55; x57 -= l14.x * x56; } __builtin_amdgcn_sched_barrier(0);
        float x58 = GDN_RHS(58); { const v4f l0 = GDN_L4(58, 0); const v4f l1 = GDN_L4(58, 1); const v4f l2 = GDN_L4(58, 2); const v4f l3 = GDN_L4(58, 3); const v4f l4 = GDN_L4(58, 4); const v4f l5 = GDN_L4(58, 5); __builtin_amdgcn_sched_barrier(0); x58 -= l0.x * x0; x58 -= l0.y * x1; x58 -= l0.z * x2; x58 -= l0.w * x3; x58 -= l1.x * x4; x58 -= l1.y * x5; x58 -= l1.z * x6; x58 -= l1.w * x7; x58 -= l2.x * x8; x58 -= l2.y * x9; x58 -= l2.z * x10; x58 -= l2.w * x11; x58 -= l3.x * x12; x58 -= l3.y * x13; x58 -= l3.z * x14; x58 -= l3.w * x15; x58 -= l4.x * x16; x58 -= l4.y * x17; x58 -= l4.z * x18; x58 -= l4.w * x19; x58 -= l5.x * x20; x58 -= l5.y * x21; x58 -= l5.z * x22; x58 -= l5.w * x23; } __builtin_amdgcn_sched_barrier(0); { const v4f l6 = GDN_L4(58, 6); const v4f l7 = GDN_L4(58, 7); const v4f l8 = GDN_L4(58, 8); const v4f l9 = GDN_L4(58, 9); const v4f l10 = GDN_L4(58, 10); const v4f l11 = GDN_L4(58, 11); __builtin_amdgcn_sched_barrier(0); x58 -= l6.x * x24; x58 -= l6.y * x25; x58 -= l6.z * x26; x58 -= l6.w * x27; x58 -= l7.x * x28; x58 -= l7.y * x29; x58 -= l7.z * x30; x58 -= l7.w * x31; x58 -= l8.x * x32; x58 -= l8.y * x33; x58 -= l8.z * x34; x58 -= l8.w * x35; x58 -= l9.x * x36; x58 -= l9.y * x37; x58 -= l9.z * x38; x58 -= l9.w * x39; x58 -= l10.x * x40; x58 -= l10.y * x41; x58 -= l10.z * x42; x58 -= l10.w * x43; x58 -= l11.x * x44; x58 -= l11.y * x45; x58 -= l11.z * x46; x58 -= l11.w * x47; } __builtin_amdgcn_sched_barrier(0); { const v4f l12 = GDN_L4(58, 12); const v4f l13 = GDN_L4(58, 13); const v4f l14 = GDN_L4(58, 14); __builtin_amdgcn_sched_barrier(0); x58 -= l12.x * x48; x58 -= l12.y * x49; x58 -= l12.z * x50; x58 -= l12.w * x51; x58 -= l13.x * x52; x58 -= l13.y * x53; x58 -= l13.z * x54; x58 -= l13.w * x55; x58 -= l14.x * x56; x58 -= l14.y * x57; } __builtin_amdgcn_sched_barrier(0);
        float x59 = GDN_RHS(59); { const v4f l0 = GDN_L4(59, 0); const v4f l1 = GDN_L4(59, 1); const v4f l2 = GDN_L4(59, 2); const v4f l3 = GDN_L4(59, 3); const v4f l4 = GDN_L4(59, 4); const v4f l5 = GDN_L4(59, 5); __builtin_amdgcn_sched_barrier(0); x59 -= l0.x * x0; x59 -= l0.y * x1; x59 -= l0.z * x2; x59 -= l0.w * x3; x59 -= l1.x * x4; x59 -= l1.y * x5; x59 -= l1.z * x6; x59 -= l1.w * x7; x59 -= l2.x * x8; x59 -= l2.y * x9; x59 -= l2.z * x10; x59 -= l2.w * x11; x59 -= l3.x * x12; x59 -= l3.y * x13; x59 -= l3.z * x14; x59 -= l3.w * x15; x59 -= l4.x * x16; x59 -= l4.y * x17; x59 -= l4.z * x18; x59 -= l4.w * x19; x59 -= l5.x * x20; x59 -= l5.y * x21; x59 -= l5.z * x22; x59 -= l5.w * x23; } __builtin_amdgcn_sched_barrier(0); { const v4f l6 = GDN_L4(59, 6); const v4f l7 = GDN_L4(59, 7); const v4f l8 = GDN_L4(59, 8); const v4f l9 = GDN_L4(59, 9); const v4f l10 = GDN_L4(59, 10); const v4f l11 = GDN_L4(59, 11); __builtin_amdgcn_sched_barrier(0); x59 -= l6.x * x24; x59 -= l6.y * x25; x59 -= l6.z * x26; x59 -= l6.w * x27; x59 -= l7.x * x28; x59 -= l7.y * x29; x59 -= l7.z * x30; x59 -= l7.w * x31; x59 -= l8.x * x32; x59 -= l8.y * x33; x59 -= l8.z * x34; x59 -= l8.w * x35; x59 -= l9.x * x36; x59 -= l9.y * x37; x59 -= l9.z * x38; x59 -= l9.w * x39; x59 -= l10.x * x40; x59 -= l10.y * x41; x59 -= l10.z * x42; x59 -= l10.w * x43; x59 -= l11.x * x44; x59 -= l11.y * x45; x59 -= l11.z * x46; x59 -= l11.w * x47; } __builtin_amdgcn_sched_barrier(0); { const v4f l12 = GDN_L4(59, 12); const v4f l13 = GDN_L4(59, 13); const v4f l14 = GDN_L4(59, 14); __builtin_amdgcn_sched_barrier(0); x59 -= l12.x * x48; x59 -= l12.y * x49; x59 -= l12.z * x50; x59 -= l12.w * x51; x59 -= l13.x * x52; x59 -= l13.y * x53; x59 -= l13.z * x54; x59 -= l13.w * x55; x59 -= l14.x * x56; x59 -= l14.y * x57; x59 -= l14.z * x58; } __builtin_amdgcn_sched_barrier(0);
        float x60 = GDN_RHS(60); { const v4f l0 = GDN_L4(60, 0); const v4f l1 = GDN_L4(60, 1); const v4f l2 = GDN_L4(60, 2); const v4f l3 = GDN_L4(60, 3); const v4f l4 = GDN_L4(60, 4); const v4f l5 = GDN_L4(60, 5); __builtin_amdgcn_sched_barrier(0); x60 -= l0.x * x0; x60 -= l0.y * x1; x60 -= l0.z * x2; x60 -= l0.w * x3; x60 -= l1.x * x4; x60 -= l1.y * x5; x60 -= l1.z * x6; x60 -= l1.w * x7; x60 -= l2.x * x8; x60 -= l2.y * x9; x60 -= l2.z * x10; x60 -= l2.w * x11; x60 -= l3.x * x12; x60 -= l3.y * x13; x60 -= l3.z * x14; x60 -= l3.w * x15; x60 -= l4.x * x16; x60 -= l4.y * x17; x60 -= l4.z * x18; x60 -= l4.w * x19; x60 -= l5.x * x20; x60 -= l5.y * x21; x60 -= l5.z * x22; x60 -= l5.w * x23; } __builtin_amdgcn_sched_barrier(0); { const v4f l6 = GDN_L4(60, 6); const v4f l7 = GDN_L4(60, 7); const v4f l8 = GDN_L4(60, 8); const v4f l9 = GDN_L4(60, 9); const v4f l10 = GDN_L4(60, 10); const v4f l11 = GDN_L4(60, 11); __builtin_amdgcn_sched_barrier(0); x60 -= l6.x * x24; x60 -= l6.y * x25; x60 -= l6.z * x26; x60 -= l6.w * x27; x60 -= l7.x * x28; x60 -= l7.y * x29; x60 -= l7.z * x30; x60 -= l7.w * x31; x60 -= l8.x * x32; x60 -= l8.y * x33; x60 -= l8.z * x34; x60 -= l8.w * x35; x60 -= l9.x * x36; x60 -= l9.y * x37; x60 -= l9.z * x38; x60 -= l9.w * x39; x60 -= l10.x * x40; x60 -= l10.y * x41; x60 -= l10.z * x42; x60 -= l10.w * x43; x60 -= l11.x * x44; x60 -= l11.y * x45; x60 -= l11.z * x46; x60 -= l11.w * x47; } __builtin_amdgcn_sched_barrier(0); { const v4f l12 = GDN_L4(60, 12); const v4f l13 = GDN_L4(60, 13); const v4f l14 = GDN_L4(60, 14); __builtin_amdgcn_sched_barrier(0); x60 -= l12.x * x48; x60 -= l12.y * x49; x60 -= l12.z * x50; x60 -= l12.w * x51; x60 -= l13.x * x52; x60 -= l13.y * x53; x60 -= l13.z * x54; x60 -= l13.w * x55; x60 -= l14.x * x56; x60 -= l14.y * x57; x60 -= l14.z * x58; x60 -= l14.w * x59; } __builtin_amdgcn_sched_barrier(0);
        float x61 = GDN_RHS(61); { const v4f l0 = GDN_L4(61, 0); const v4f l1 = GDN_L4(61, 1); const v4f l2 = GDN_L4(61, 2); const v4f l3 = GDN_L4(61, 3); const v4f l4 = GDN_L4(61, 4); const v4f l5 = GDN_L4(61, 5); __builtin_amdgcn_sched_barrier(0); x61 -= l0.x * x0; x61 -= l0.y * x1; x61 -= l0.z * x2; x61 -= l0.w * x3; x61 -= l1.x * x4; x61 -= l1.y * x5; x61 -= l1.z * x6; x61 -= l1.w * x7; x61 -= l2.x * x8; x61 -= l2.y * x9; x61 -= l2.z * x10; x61 -= l2.w * x11; x61 -= l3.x * x12; x61 -= l3.y * x13; x61 -= l3.z * x14; x61 -= l3.w * x15; x61 -= l4.x * x16; x61 -= l4.y * x17; x61 -= l4.z * x18; x61 -= l4.w * x19; x61 -= l5.x * x20; x61 -= l5.y * x21; x61 -= l5.z * x22; x61 -= l5.w * x23; } __builtin_amdgcn_sched_barrier(0); { const v4f l6 = GDN_L4(61, 6); const v4f l7 = GDN_L4(61, 7); const v4f l8 = GDN_L4(61, 8); const v4f l9 = GDN_L4(61, 9); const v4f l10 = GDN_L4(61, 10); const v4f l11 = GDN_L4(61, 11); __builtin_amdgcn_sched_barrier(0); x61 -= l6.x * x24; x61 -= l6.y * x25; x61 -= l6.z * x26; x61 -= l6.w * x27; x61 -= l7.x * x28; x61 -= l7.y * x29; x61 -= l7.z * x30; x61 -= l7.w * x31; x61 -= l8.x * x32; x61 -= l8.y * x33; x61 -= l8.z * x34; x61 -= l8.w * x35; x61 -= l9.x * x36; x61 -= l9.y * x37; x61 -= l9.z * x38; x61 -= l9.w * x39; x61 -= l10.x * x40; x61 -= l10.y * x41; x61 -= l10.z * x42; x61 -= l10.w * x43; x61 -= l11.x * x44; x61 -= l11.y * x45; x61 -= l11.z * x46; x61 -= l11.w * x47; } __builtin_amdgcn_sched_barrier(0); { const v4f l12 = GDN_L4(61, 12); const v4f l13 = GDN_L4(61, 13); const v4f l14 = GDN_L4(61, 14); const v4f l15 = GDN_L4(61, 15); __builtin_amdgcn_sched_barrier(0); x61 -= l12.x * x48; x61 -= l12.y * x49; x61 -= l12.z * x50; x61 -= l12.w * x51; x61 -= l13.x * x52; x61 -= l13.y * x53; x61 -= l13.z * x54; x61 -= l13.w * x55; x61 -= l14.x * x56; x61 -= l14.y * x57; x61 -= l14.z * x58; x61 -= l14.w * x59; x61 -= l15.x * x60; } __builtin_amdgcn_sched_barrier(0);
        float x62 = GDN_RHS(62); { const v4f l0 = GDN_L4(62, 0); const v4f l1 = GDN_L4(62, 1); const v4f l2 = GDN_L4(62, 2); const v4f l3 = GDN_L4(62, 3); const v4f l4 = GDN_L4(62, 4); const v4f l5 = GDN_L4(62, 5); __builtin_amdgcn_sched_barrier(0); x62 -= l0.x * x0; x62 -= l0.y * x1; x62 -= l0.z * x2; x62 -= l0.w * x3; x62 -= l1.x * x4; x62 -= l1.y * x5; x62 -= l1.z * x6; x62 -= l1.w * x7; x62 -= l2.x * x8; x62 -= l2.y * x9; x62 -= l2.z * x10; x62 -= l2.w * x11; x62 -= l3.x * x12; x62 -= l3.y * x13; x62 -= l3.z * x14; x62 -= l3.w * x15; x62 -= l4.x * x16; x62 -= l4.y * x17; x62 -= l4.z * x18; x62 -= l4.w * x19; x62 -= l5.x * x20; x62 -= l5.y * x21; x62 -= l5.z * x22; x62 -= l5.w * x23; } __builtin_amdgcn_sched_barrier(0); { const v4f l6 = GDN_L4(62, 6); const v4f l7 = GDN_L4(62, 7); const v4f l8 = GDN_L4(62, 8); const v4f l9 = GDN_L4(62, 9); const v4f l10 = GDN_L4(62, 10); const v4f l11 = GDN_L4(62, 11); __builtin_amdgcn_sched_barrier(0); x62 -= l6.x * x24; x62 -= l6.y * x25; x62 -= l6.z * x26; x62 -= l6.w * x27; x62 -= l7.x * x28; x62 -= l7.y * x29; x62 -= l7.z * x30; x62 -= l7.w * x31; x62 -= l8.x * x32; x62 -= l8.y * x33; x62 -= l8.z * x34; x62 -= l8.w * x35; x62 -= l9.x * x36; x62 -= l9.y * x37; x62 -= l9.z * x38; x62 -= l9.w * x39; x62 -= l10.x * x40; x62 -= l10.y * x41; x62 -= l10.z * x42; x62 -= l10.w * x43; x62 -= l11.x * x44; x62 -= l11.y * x45; x62 -= l11.z * x46; x62 -= l11.w * x47; } __builtin_amdgcn_sched_barrier(0); { const v4f l12 = GDN_L4(62, 12); const v4f l13 = GDN_L4(62, 13); const v4f l14 = GDN_L4(62, 14); const v4f l15 = GDN_L4(62, 15); __builtin_amdgcn_sched_barrier(0); x62 -= l12.x * x48; x62 -= l12.y * x49; x62 -= l12.z * x50; x62 -= l12.w * x51; x62 -= l13.x * x52; x62 -= l13.y * x53; x62 -= l13.z * x54; x62 -= l13.w * x55; x62 -= l14.x * x56; x62 -= l14.y * x57; x62 -= l14.z * x58; x62 -= l14.w * x59; x62 -= l15.x * x60; x62 -= l15.y * x61; } __builtin_amdgcn_sched_barrier(0);
        float x63 = GDN_RHS(63); { const v4f l0 = GDN_L4(63, 0); const v4f l1 = GDN_L4(63, 1); const v4f l2 = GDN_L4(63, 2); const v4f l3 = GDN_L4(63, 3); const v4f l4 = GDN_L4(63, 4); const v4f l5 = GDN_L4(63, 5); __builtin_amdgcn_sched_barrier(0); x63 -= l0.x * x0; x63 -= l0.y * x1; x63 -= l0.z * x2; x63 -= l0.w * x3; x63 -= l1.x * x4; x63 -= l1.y * x5; x63 -= l1.z * x6; x63 -= l1.w * x7; x63 -= l2.x * x8; x63 -= l2.y * x9; x63 -= l2.z * x10; x63 -= l2.w * x11; x63 -= l3.x * x12; x63 -= l3.y * x13; x63 -= l3.z * x14; x63 -= l3.w * x15; x63 -= l4.x * x16; x63 -= l4.y * x17; x63 -= l4.z * x18; x63 -= l4.w * x19; x63 -= l5.x * x20; x63 -= l5.y * x21; x63 -= l5.z * x22; x63 -= l5.w * x23; } __builtin_amdgcn_sched_barrier(0); { const v4f l6 = GDN_L4(63, 6); const v4f l7 = GDN_L4(63, 7); const v4f l8 = GDN_L4(63, 8); const v4f l9 = GDN_L4(63, 9); const v4f l10 = GDN_L4(63, 10); const v4f l11 = GDN_L4(63, 11); __builtin_amdgcn_sched_barrier(0); x63 -= l6.x * x24; x63 -= l6.y * x25; x63 -= l6.z * x26; x63 -= l6.w * x27; x63 -= l7.x * x28; x63 -= l7.y * x29; x63 -= l7.z * x30; x63 -= l7.w * x31; x63 -= l8.x * x32; x63 -= l8.y * x33; x63 -= l8.z * x34; x63 -= l8.w * x35; x63 -= l9.x * x36; x63 -= l9.y * x37; x63 -= l9.z * x38; x63 -= l9.w * x39; x63 -= l10.x * x40; x63 -= l10.y * x41; x63 -= l10.z * x42; x63 -= l10.w * x43; x63 -= l11.x * x44; x63 -= l11.y * x45; x63 -= l11.z * x46; x63 -= l11.w * x47; } __builtin_amdgcn_sched_barrier(0); { const v4f l12 = GDN_L4(63, 12); const v4f l13 = GDN_L4(63, 13); const v4f l14 = GDN_L4(63, 14); const v4f l15 = GDN_L4(63, 15); __builtin_amdgcn_sched_barrier(0); x63 -= l12.x * x48; x63 -= l12.y * x49; x63 -= l12.z * x50; x63 -= l12.w * x51; x63 -= l13.x * x52; x63 -= l13.y * x53; x63 -= l13.z * x54; x63 -= l13.w * x55; x63 -= l14.x * x56; x63 -= l14.y * x57; x63 -= l14.z * x58; x63 -= l14.w * x59; x63 -= l15.x * x60; x63 -= l15.y * x61; x63 -= l15.z * x62; } __builtin_amdgcn_sched_barrier(0);
        if (c < 128) { GU[0 * 128 + c] = x0; GU[1 * 128 + c] = x1; GU[2 * 128 + c] = x2; GU[3 * 128 + c] = x3; GU[4 * 128 + c] = x4; GU[5 * 128 + c] = x5; GU[6 * 128 + c] = x6; GU[7 * 128 + c] = x7; GU[8 * 128 + c] = x8; GU[9 * 128 + c] = x9; GU[10 * 128 + c] = x10; GU[11 * 128 + c] = x11; GU[12 * 128 + c] = x12; GU[13 * 128 + c] = x13; GU[14 * 128 + c] = x14; GU[15 * 128 + c] = x15; GU[16 * 128 + c] = x16; GU[17 * 128 + c] = x17; GU[18 * 128 + c] = x18; GU[19 * 128 + c] = x19; GU[20 * 128 + c] = x20; GU[21 * 128 + c] = x21; GU[22 * 128 + c] = x22; GU[23 * 128 + c] = x23; GU[24 * 128 + c] = x24; GU[25 * 128 + c] = x25; GU[26 * 128 + c] = x26; GU[27 * 128 + c] = x27; GU[28 * 128 + c] = x28; GU[29 * 128 + c] = x29; GU[30 * 128 + c] = x30; GU[31 * 128 + c] = x31; GU[32 * 128 + c] = x32; GU[33 * 128 + c] = x33; GU[34 * 128 + c] = x34; GU[35 * 128 + c] = x35; GU[36 * 128 + c] = x36; GU[37 * 128 + c] = x37; GU[38 * 128 + c] = x38; GU[39 * 128 + c] = x39; GU[40 * 128 + c] = x40; GU[41 * 128 + c] = x41; GU[42 * 128 + c] = x42; GU[43 * 128 + c] = x43; GU[44 * 128 + c] = x44; GU[45 * 128 + c] = x45; GU[46 * 128 + c] = x46; GU[47 * 128 + c] = x47; GU[48 * 128 + c] = x48; GU[49 * 128 + c] = x49; GU[50 * 128 + c] = x50; GU[51 * 128 + c] = x51; GU[52 * 128 + c] = x52; GU[53 * 128 + c] = x53; GU[54 * 128 + c] = x54; GU[55 * 128 + c] = x55; GU[56 * 128 + c] = x56; GU[57 * 128 + c] = x57; GU[58 * 128 + c] = x58; GU[59 * 128 + c] = x59; GU[60 * 128 + c] = x60; GU[61 * 128 + c] = x61; GU[62 * 128 + c] = x62; GU[63 * 128 + c] = x63; }
        else { GNW[0 * 128 + (c - 128)] = (bf16)f2bf(-x0); GNW[1 * 128 + (c - 128)] = (bf16)f2bf(-x1); GNW[2 * 128 + (c - 128)] = (bf16)f2bf(-x2); GNW[3 * 128 + (c - 128)] = (bf16)f2bf(-x3); GNW[4 * 128 + (c - 128)] = (bf16)f2bf(-x4); GNW[5 * 128 + (c - 128)] = (bf16)f2bf(-x5); GNW[6 * 128 + (c - 128)] = (bf16)f2bf(-x6); GNW[7 * 128 + (c - 128)] = (bf16)f2bf(-x7); GNW[8 * 128 + (c - 128)] = (bf16)f2bf(-x8); GNW[9 * 128 + (c - 128)] = (bf16)f2bf(-x9); GNW[10 * 128 + (c - 128)] = (bf16)f2bf(-x10); GNW[11 * 128 + (c - 128)] = (bf16)f2bf(-x11); GNW[12 * 128 + (c - 128)] = (bf16)f2bf(-x12); GNW[13 * 128 + (c - 128)] = (bf16)f2bf(-x13); GNW[14 * 128 + (c - 128)] = (bf16)f2bf(-x14); GNW[15 * 128 + (c - 128)] = (bf16)f2bf(-x15); GNW[16 * 128 + (c - 128)] = (bf16)f2bf(-x16); GNW[17 * 128 + (c - 128)] = (bf16)f2bf(-x17); GNW[18 * 128 + (c - 128)] = (bf16)f2bf(-x18); GNW[19 * 128 + (c - 128)] = (bf16)f2bf(-x19); GNW[20 * 128 + (c - 128)] = (bf16)f2bf(-x20); GNW[21 * 128 + (c - 128)] = (bf16)f2bf(-x21); GNW[22 * 128 + (c - 128)] = (bf16)f2bf(-x22); GNW[23 * 128 + (c - 128)] = (bf16)f2bf(-x23); GNW[24 * 128 + (c - 128)] = (bf16)f2bf(-x24); GNW[25 * 128 + (c - 128)] = (bf16)f2bf(-x25); GNW[26 * 128 + (c - 128)] = (bf16)f2bf(-x26); GNW[27 * 128 + (c - 128)] = (bf16)f2bf(-x27); GNW[28 * 128 + (c - 128)] = (bf16)f2bf(-x28); GNW[29 * 128 + (c - 128)] = (bf16)f2bf(-x29); GNW[30 * 128 + (c - 128)] = (bf16)f2bf(-x30); GNW[31 * 128 + (c - 128)] = (bf16)f2bf(-x31); GNW[32 * 128 + (c - 128)] = (bf16)f2bf(-x32); GNW[33 * 128 + (c - 128)] = (bf16)f2bf(-x33); GNW[34 * 128 + (c - 128)] = (bf16)f2bf(-x34); GNW[35 * 128 + (c - 128)] = (bf16)f2bf(-x35); GNW[36 * 128 + (c - 128)] = (bf16)f2bf(-x36); GNW[37 * 128 + (c - 128)] = (bf16)f2bf(-x37); GNW[38 * 128 + (c - 128)] = (bf16)f2bf(-x38); GNW[39 * 128 + (c - 128)] = (bf16)f2bf(-x39); GNW[40 * 128 + (c - 128)] = (bf16)f2bf(-x40); GNW[41 * 128 + (c - 128)] = (bf16)f2bf(-x41); GNW[42 * 128 + (c - 128)] = (bf16)f2bf(-x42); GNW[43 * 128 + (c - 128)] = (bf16)f2bf(-x43); GNW[44 * 128 + (c - 128)] = (bf16)f2bf(-x44); GNW[45 * 128 + (c - 128)] = (bf16)f2bf(-x45); GNW[46 * 128 + (c - 128)] = (bf16)f2bf(-x46); GNW[47 * 128 + (c - 128)] = (bf16)f2bf(-x47); GNW[48 * 128 + (c - 128)] = (bf16)f2bf(-x48); GNW[49 * 128 + (c - 128)] = (bf16)f2bf(-x49); GNW[50 * 128 + (c - 128)] = (bf16)f2bf(-x50); GNW[51 * 128 + (c - 128)] = (bf16)f2bf(-x51); GNW[52 * 128 + (c - 128)] = (bf16)f2bf(-x52); GNW[53 * 128 + (c - 128)] = (bf16)f2bf(-x53); GNW[54 * 128 + (c - 128)] = (bf16)f2bf(-x54); GNW[55 * 128 + (c - 128)] = (bf16)f2bf(-x55); GNW[56 * 128 + (c - 128)] = (bf16)f2bf(-x56); GNW[57 * 128 + (c - 128)] = (bf16)f2bf(-x57); GNW[58 * 128 + (c - 128)] = (bf16)f2bf(-x58); GNW[59 * 128 + (c - 128)] = (bf16)f2bf(-x59); GNW[60 * 128 + (c - 128)] = (bf16)f2bf(-x60); GNW[61 * 128 + (c - 128)] = (bf16)f2bf(-x61); GNW[62 * 128 + (c - 128)] = (bf16)f2bf(-x62); GNW[63 * 128 + (c - 128)] = (bf16)f2bf(-x63); }
#undef GDN_RHS
#undef GDN_L4
    } else {
        const int t2 = tid - 256; const float gl = gcs[63];
        { const int i = t2 >> 2, d0 = (t2 & 3) * 32; const float e = __expf(gcs[i]);
#pragma unroll
          for (int x8 = 0; x8 < 4; ++x8) { const v4f a = *(const LAS v4f*)(qs + i * QP + d0 + 8 * x8), b = *(const LAS v4f*)(qs + i * QP + d0 + 8 * x8 + 4);
              v4u w; w.x = pk2(a.x * e, a.y * e); w.y = pk2(a.z * e, a.w * e); w.z = pk2(b.x * e, b.y * e); w.w = pk2(b.z * e, b.w * e); *(v4u*)(GQG + i * 128 + d0 + 8 * x8) = w; } }
        { const int d = t2 >> 1, j0 = (t2 & 1) * 32;
#pragma unroll
          for (int x8 = 0; x8 < 4; ++x8) { float o[8];
#pragma unroll
              for (int x = 0; x < 8; ++x) { const int j = j0 + 8 * x8 + x; o[x] = ks[j * QP + d] * __expf(gl - gcs[j]); }
              v4u w; w.x = pk2(o[0], o[1]); w.y = pk2(o[2], o[3]); w.z = pk2(o[4], o[5]); w.w = pk2(o[6], o[7]); *(v4u*)(GKT + d * 64 + j0 + 8 * x8) = w; } }
        if (t2 == 0) GDL[item] = __expf(gl);
    }
    __syncthreads();
}
struct GdnFrags { bf16x8_t nw[4], qg[4], at[2], kt[2][2]; float u[4]; float dl; };
__device__ __forceinline__ void gdn_load(GdnFrags& F, const Params& p, int item, int off128, int off64, int offk, int offu) {
    const bf16* GNW = (const bf16*)(p.ws + WS_GNW) + (size_t)item * 8192; const bf16* GQG = (const bf16*)(p.ws + WS_GQG) + (size_t)item * 8192;
    const bf16* GAT = (const bf16*)(p.ws + WS_GAT) + (size_t)item * 4096; const bf16* GKT = (const bf16*)(p.ws + WS_GKT) + (size_t)item * 8192; const float* GU = (const float*)(p.ws + WS_GU) + (size_t)item * 8192;
#pragma unroll
    for (int ks = 0; ks < 4; ++ks) { F.nw[ks] = *(const bf16x8_t*)(GNW + off128 + 32 * ks); F.qg[ks] = *(const bf16x8_t*)(GQG + off128 + 32 * ks); }
#pragma unroll
    for (int ks = 0; ks < 2; ++ks) { F.at[ks] = *(const bf16x8_t*)(GAT + off64 + 32 * ks); F.kt[0][ks] = *(const bf16x8_t*)(GKT + offk + 32 * ks); F.kt[1][ks] = *(const bf16x8_t*)(GKT + offk + 1024 + 32 * ks); }
#pragma unroll
    for (int r = 0; r < 4; ++r) F.u[r] = GU[offu + r * 128];
    F.dl = ((const float*)(p.ws + WS_GDL))[item];
}
constexpr int STP = 136, VNP = 72;
__device__ __forceinline__ void gdn_seq(const Params& p, LAS unsigned char* lds, int wgi, int wave, int lane) {
    const int u = wgi * 2 + (wave >> 2), wi = wave & 3, h = u >> 3, sl = u & 7, g = lane >> 4, c = lane & 15;
    LAS unsigned short* ST = (LAS unsigned short*)(lds + (wave >> 2) * 12288);
    LAS unsigned short* VNT = ST + 2 * 16 * STP;
    float* GO = (float*)(p.ws + WS_GO);
    const int off128 = (16 * wi + c) * 128 + 8 * g, off64 = (16 * wi + c) * 64 + 8 * g, offk = (32 * wi + c) * 64 + 8 * g, offu = (16 * wi + 4 * g) * 128 + 16 * sl + c;
#pragma unroll
    for (int mt = 0; mt < 2; ++mt) *(LAS v2u*)(ST + c * STP + 16 * (2 * wi + mt) + 4 * g) = (v2u){0u, 0u};
    pg8::f32x4 Sacc[2] = {{0.f, 0.f, 0.f, 0.f}, {0.f, 0.f, 0.f, 0.f}};
    __syncthreads();
    GdnFrags F0, F1;
    gdn_load(F0, p, h, off128, off64, offk, offu);
#define GDN_STEP(F, n_) do { const int cur = (n_) & 1; bf16x8_t sf[4]; \
        _Pragma("unroll") for (int ks = 0; ks < 4; ++ks) sf[ks] = *(const LAS bf16x8_t*)(ST + cur * 16 * STP + c * STP + 32 * ks + 8 * g); \
        pg8::f32x4 vn = {F.u[0], F.u[1], F.u[2], F.u[3]}; \
        _Pragma("unroll") for (int ks = 0; ks < 4; ++ks) vn = __builtin_amdgcn_mfma_f32_16x16x32_bf16(F.nw[ks], sf[ks], vn, 0, 0, 0); \
        { v2u w; w.x = pk2(vn[0], vn[1]); w.y = pk2(vn[2], vn[3]); *(LAS v2u*)(VNT + c * VNP + 16 * wi + 4 * g) = w; } \
        LDS_BAR(); \
        const bf16x8_t v0 = *(const LAS bf16x8_t*)(VNT + c * VNP + 8 * g), v1 = *(const LAS bf16x8_t*)(VNT + c * VNP + 32 + 8 * g); \
        pg8::f32x4 o = {0.f, 0.f, 0.f, 0.f}; \
        _Pragma("unroll") for (int ks = 0; ks < 4; ++ks) o = __builtin_amdgcn_mfma_f32_16x16x32_bf16(F.qg[ks], sf[ks], o, 0, 0, 0); \
        o = __builtin_amdgcn_mfma_f32_16x16x32_bf16(F.at[0], v0, o, 0, 0, 0); o = __builtin_amdgcn_mfma_f32_16x16x32_bf16(F.at[1], v1, o, 0, 0, 0); \
        { const size_t tb = (size_t)(n_) * 64 + 16 * wi + 4 * g; _Pragma("unroll") for (int r = 0; r < 4; ++r) GO[(tb + r) * BW + h * 128 + 16 * sl + c] = o[r]; } \
        _Pragma("unroll") for (int mt = 0; mt < 2; ++mt) { Sacc[mt] = Sacc[mt] * F.dl; \
            Sacc[mt] = __builtin_amdgcn_mfma_f32_16x16x32_bf16(F.kt[mt][0], v0, Sacc[mt], 0, 0, 0); Sacc[mt] = __builtin_amdgcn_mfma_f32_16x16x32_bf16(F.kt[mt][1], v1, Sacc[mt], 0, 0, 0); \
            v2u w; w.x = pk2(Sacc[mt][0], Sacc[mt][1]); w.y = pk2(Sacc[mt][2], Sacc[mt][3]); *(LAS v2u*)(ST + (cur ^ 1) * 16 * STP + c * STP + 16 * (2 * wi + mt) + 4 * g) = w; } \
        LDS_BAR(); } while (0)
    for (int n = 0; n < T / 64; n += 2) {
        gdn_load(F1, p, (n + 1) * 4 + h, off128, off64, offk, offu);
        GDN_STEP(F0, n);
        gdn_load(F0, p, ((n + 2 < T / 64) ? n + 2 : n) * 4 + h, off128, off64, offk, offu);
        GDN_STEP(F1, n + 1);
    }
#undef GDN_STEP
}

constexpr int SEQ_UOFF = 132096;
constexpr int GI_NW = 0, GI_QG = 8704, GI_AT = 17408, GI_KT = 22016, GI_SZ = 31232;
struct GdnStage { v4u r[7]; float u[4]; float dl; };
__device__ __forceinline__ void gdn_stage_load(GdnStage& Sg, const Params& p, int item, int tid, int offu) {
    const bf16* GNW = (const bf16*)(p.ws + WS_GNW) + (size_t)item * 8192; const bf16* GQG = (const bf16*)(p.ws + WS_GQG) + (size_t)item * 8192;
    const bf16* GAT = (const bf16*)(p.ws + WS_GAT) + (size_t)item * 4096; const bf16* GKT = (const bf16*)(p.ws + WS_GKT) + (size_t)item * 8192; const float* GU = (const float*)(p.ws + WS_GU) + (size_t)item * 8192;
    Sg.r[0] = *(const v4u*)(GNW + 8 * tid); Sg.r[1] = *(const v4u*)(GNW + 8 * (tid + 512)); Sg.r[2] = *(const v4u*)(GQG + 8 * tid); Sg.r[3] = *(const v4u*)(GQG + 8 * (tid + 512));
    Sg.r[4] = *(const v4u*)(GAT + 8 * tid); Sg.r[5] = *(const v4u*)(GKT + 8 * tid); Sg.r[6] = *(const v4u*)(GKT + 8 * (tid + 512));
#pragma unroll
    for (int r = 0; r < 4; ++r) Sg.u[r] = GU[offu + r * 128];
    Sg.dl = ((const float*)(p.ws + WS_GDL))[item];
}
__device__ __forceinline__ void gdn_stage_write(const GdnStage& Sg, LAS unsigned short* img, int tid) {
    { const int p0 = tid, p1 = tid + 512;
      *(LAS v4u*)(img + GI_NW + (p0 >> 4) * 136 + 8 * (p0 & 15)) = Sg.r[0]; *(LAS v4u*)(img + GI_NW + (p1 >> 4) * 136 + 8 * (p1 & 15)) = Sg.r[1];
      *(LAS v4u*)(img + GI_QG + (p0 >> 4) * 136 + 8 * (p0 & 15)) = Sg.r[2]; *(LAS v4u*)(img + GI_QG + (p1 >> 4) * 136 + 8 * (p1 & 15)) = Sg.r[3];
      *(LAS v4u*)(img + GI_AT + (p0 >> 3) * 72 + 8 * (p0 & 7)) = Sg.r[4];
      *(LAS v4u*)(img + GI_KT + (p0 >> 3) * 72 + 8 * (p0 & 7)) = Sg.r[5]; *(LAS v4u*)(img + GI_KT + (p1 >> 3) * 72 + 8 * (p1 & 7)) = Sg.r[6]; }
}
__device__ __forceinline__ void gdn_seq2(const Params& p, LAS unsigned char* lds, int wgi, int tid, int wave, int lane) {
    const int h = wgi >> 2, sl = 2 * (wgi & 3) + (wave >> 2), wi = wave & 3, g = lane >> 4, c = lane & 15;
    LAS unsigned short* IMG = (LAS unsigned short*)lds;
    LAS unsigned short* ST = (LAS unsigned short*)(lds + SEQ_UOFF + (wave >> 2) * 12288);
    LAS unsigned short* VNT = ST + 2 * 16 * STP;
    float* GO = (float*)(p.ws + WS_GO);
    const int offu = (16 * wi + 4 * g) * 128 + 16 * sl + c;
#pragma unroll
    for (int mt = 0; mt < 2; ++mt) *(LAS v2u*)(ST + c * STP + 16 * (2 * wi + mt) + 4 * g) = (v2u){0u, 0u};
    pg8::f32x4 Sacc[2] = {{0.f, 0.f, 0.f, 0.f}, {0.f, 0.f, 0.f, 0.f}};
    GdnStage A, B;
    gdn_stage_load(A, p, h, tid, offu); gdn_stage_write(A, IMG, tid);
    gdn_stage_load(B, p, 4 + h, tid, offu);
    LDS_BAR();
    constexpr int NCH = T / 64;
#define GDN_STEP2(X, Y, n_) do { const int cur = (n_) & 1; const LAS unsigned short* im = IMG + cur * GI_SZ; bf16x8_t sf[4]; \
        _Pragma("unroll") for (int ks = 0; ks < 4; ++ks) sf[ks] = *(const LAS bf16x8_t*)(ST + cur * 16 * STP + c * STP + 32 * ks + 8 * g); \
        pg8::f32x4 vn = {X.u[0], X.u[1], X.u[2], X.u[3]}; const float dl = X.dl; \
        _Pragma("unroll") for (int ks = 0; ks < 4; ++ks) vn = __builtin_amdgcn_mfma_f32_16x16x32_bf16(*(const LAS bf16x8_t*)(im + GI_NW + (16 * wi + c) * 136 + 32 * ks + 8 * g), sf[ks], vn, 0, 0, 0); \
        { v2u w; w.x = pk2(vn[0], vn[1]); w.y = pk2(vn[2], vn[3]); *(LAS v2u*)(VNT + c * VNP + 16 * wi + 4 * g) = w; } \
        pg8::f32x4 o = {0.f, 0.f, 0.f, 0.f}; \
        _Pragma("unroll") for (int ks = 0; ks < 4; ++ks) o = __builtin_amdgcn_mfma_f32_16x16x32_bf16(*(const LAS bf16x8_t*)(im + GI_QG + (16 * wi + c) * 136 + 32 * ks + 8 * g), sf[ks], o, 0, 0, 0); \
        LDS_BAR(); \
        gdn_stage_load(X, p, (((n_) + 2 < NCH) ? (n_) + 2 : (n_)) * 4 + h, tid, offu); \
        const bf16x8_t v0 = *(const LAS bf16x8_t*)(VNT + c * VNP + 8 * g), v1 = *(const LAS bf16x8_t*)(VNT + c * VNP + 32 + 8 * g); \
        o = __builtin_amdgcn_mfma_f32_16x16x32_bf16(*(const LAS bf16x8_t*)(im + GI_AT + (16 * wi + c) * 72 + 8 * g), v0, o, 0, 0, 0); \
        o = __builtin_amdgcn_mfma_f32_16x16x32_bf16(*(const LAS bf16x8_t*)(im + GI_AT + (16 * wi + c) * 72 + 32 + 8 * g), v1, o, 0, 0, 0); \
        { const size_t tb = (size_t)(n_) * 64 + 16 * wi + 4 * g; _Pragma("unroll") for (int r = 0; r < 4; ++r) GO[(tb + r) * BW + h * 128 + 16 * sl + c] = o[r]; } \
        _Pragma("unroll") for (int mt = 0; mt < 2; ++mt) { Sacc[mt] = Sacc[mt] * dl; \
            Sacc[mt] = __builtin_amdgcn_mfma_f32_16x16x32_bf16(*(const LAS bf16x8_t*)(im + GI_KT + (16 * (2 * wi + mt) + c) * 72 + 8 * g), v0, Sacc[mt], 0, 0, 0); \
            Sacc[mt] = __builtin_amdgcn_mfma_f32_16x16x32_bf16(*(const LAS bf16x8_t*)(im + GI_KT + (16 * (2 * wi + mt) + c) * 72 + 32 + 8 * g), v1, Sacc[mt], 0, 0, 0); \
            v2u w; w.x = pk2(Sacc[mt][0], Sacc[mt][1]); w.y = pk2(Sacc[mt][2], Sacc[mt][3]); *(LAS v2u*)(ST + (cur ^ 1) * 16 * STP + c * STP + 16 * (2 * wi + mt) + 4 * g) = w; } \
        gdn_stage_write(Y, IMG + (cur ^ 1) * GI_SZ, tid); \
        LDS_BAR(); } while (0)
    for (int n = 0; n < NCH; n += 2) { GDN_STEP2(A, B, n); GDN_STEP2(B, A, n + 1); }
#undef GDN_STEP2
}
constexpr int MI_Q = 0, MI_S = 4608, MI_K = 9216, MI_SZ = 13824;
struct MlStage { v4u r[3]; bf16x8_t vt[2]; float fl; };
__device__ __forceinline__ void ml_stage_load(MlStage& Sg, const Params& p, int item, int tid, int offV) {
    const bf16* MQ = (const bf16*)(p.ws + WS_MQ) + (size_t)item * 4096; const bf16* MS = (const bf16*)(p.ws + WS_MS) + (size_t)item * 4096; const bf16* MK = (const bf16*)(p.ws + WS_MK) + (size_t)item * 4096;
    const bf16* MV = (const bf16*)(p.ws + WS_MV) + (size_t)item * 9216;
    Sg.r[0] = *(const v4u*)(MQ + 8 * tid); Sg.r[1] = *(const v4u*)(MS + 8 * tid); Sg.r[2] = *(const v4u*)(MK + 8 * tid);
    Sg.vt[0] = *(const bf16x8_t*)(MV + offV); Sg.vt[1] = *(const bf16x8_t*)(MV + offV + 32);
    Sg.fl = ((const float*)(p.ws + WS_MFL))[item];
}
__device__ __forceinline__ void ml_stage_write(const MlStage& Sg, LAS unsigned short* img, int tid) {
    const int o = (tid >> 3) * 72 + 8 * (tid & 7);
    *(LAS v4u*)(img + MI_Q + o) = Sg.r[0]; *(LAS v4u*)(img + MI_S + o) = Sg.r[1]; *(LAS v4u*)(img + MI_K + o) = Sg.r[2];
}
__device__ __forceinline__ void ml_seq2(const Params& p, LAS unsigned char* lds, int wgi, int tid, int wave, int lane) {
    const int h = wgi / 5, sl0 = 2 * (wgi % 5) + (wave >> 2), wi = wave & 3, g = lane >> 4, c = lane & 15;
    const bool real = sl0 < 9; const int sl = real ? sl0 : 8;
    LAS unsigned short* IMG = (LAS unsigned short*)lds;
    LAS unsigned short* CT = (LAS unsigned short*)(lds + SEQ_UOFF + (wave >> 2) * 8192);
    float* HO = (float*)(p.ws + WS_HO); float* HDEN = (float*)(p.ws + WS_HDEN);
    const int offV = (16 * sl + c) * 64 + 8 * g;
    *(LAS v2u*)(CT + c * 72 + 16 * wi + 4 * g) = (v2u){0u, 0u};
    pg8::f32x4 Cacc = {0.f, 0.f, 0.f, 0.f};
    MlStage A, B;
    ml_stage_load(A, p, h, tid, offV); ml_stage_write(A, IMG, tid);
    ml_stage_load(B, p, 4 + h, tid, offV);
    LDS_BAR();
    constexpr int NCH = T / 64;
#define ML_STEP2(X, Y, n_) do { const int cur = (n_) & 1; const LAS unsigned short* im = IMG + cur * MI_SZ; const int ro = (16 * wi + c) * 72 + 8 * g; \
        const bf16x8_t c0 = *(const LAS bf16x8_t*)(CT + cur * 16 * 72 + c * 72 + 8 * g), c1 = *(const LAS bf16x8_t*)(CT + cur * 16 * 72 + c * 72 + 32 + 8 * g); \
        const bf16x8_t vt0 = X.vt[0], vt1 = X.vt[1]; const float fl = X.fl; \
        pg8::f32x4 num = {0.f, 0.f, 0.f, 0.f}; \
        num = __builtin_amdgcn_mfma_f32_16x16x32_bf16(*(const LAS bf16x8_t*)(im + MI_Q + ro), c0, num, 0, 0, 0); num = __builtin_amdgcn_mfma_f32_16x16x32_bf16(*(const LAS bf16x8_t*)(im + MI_Q + ro + 32), c1, num, 0, 0, 0); \
        num = __builtin_amdgcn_mfma_f32_16x16x32_bf16(*(const LAS bf16x8_t*)(im + MI_S + ro), vt0, num, 0, 0, 0); num = __builtin_amdgcn_mfma_f32_16x16x32_bf16(*(const LAS bf16x8_t*)(im + MI_S + ro + 32), vt1, num, 0, 0, 0); \
        Cacc = Cacc * fl; \
        Cacc = __builtin_amdgcn_mfma_f32_16x16x32_bf16(*(const LAS bf16x8_t*)(im + MI_K + ro), vt0, Cacc, 0, 0, 0); Cacc = __builtin_amdgcn_mfma_f32_16x16x32_bf16(*(const LAS bf16x8_t*)(im + MI_K + ro + 32), vt1, Cacc, 0, 0, 0); \
        ml_stage_load(X, p, (((n_) + 2 < NCH) ? (n_) + 2 : (n_)) * 4 + h, tid, offV); \
        { v2u w; w.x = pk2(Cacc[0], Cacc[1]); w.y = pk2(Cacc[2], Cacc[3]); *(LAS v2u*)(CT + (cur ^ 1) * 16 * 72 + c * 72 + 16 * wi + 4 * g) = w; } \
        { const size_t tb = (size_t)(n_) * 64 + 16 * wi + 4 * g; \
          if (sl < 8) { _Pragma("unroll") for (int r = 0; r < 4; ++r) HO[(tb + r) * BW + h * 128 + 16 * sl + c] = num[r]; } \
          else if (c == 0 && real) { _Pragma("unroll") for (int r = 0; r < 4; ++r) HDEN[(tb + r) * 4 + h] = num[r]; } } \
        ml_stage_write(Y, IMG + (cur ^ 1) * MI_SZ, tid); \
        LDS_BAR(); } while (0)
    for (int n = 0; n < NCH; n += 2) { ML_STEP2(A, B, n); ML_STEP2(B, A, n + 1); }
#undef ML_STEP2
}

__device__ __forceinline__ void mixer_gmlp_item(const Params& p, int l, LAS unsigned char* lds, int item, int tid, int wave, int lane) {
    const int chunk = item >> 2, g = item & 3; const size_t tok0 = (size_t)chunk * 128;
    const bf16* Z = (const bf16*)(p.ws + WS_Z);
    const float* ng = p.in[I_GMNG] + l * BW; const float* nb = p.in[I_GMNB] + l * BW;
    const float* wsp = p.in[I_GMWS] + ((size_t)(l * 4 + g) * 128) * 128; const float* bsp = p.in[I_GMBS] + (l * 4 + g) * 128;
    LAS unsigned short* vT = (LAS unsigned short*)lds;
    {   v4u raw[16];
#pragma unroll
        for (int r = 0; r < 16; ++r) raw[r] = *(const v4u*)(Z + (tok0 + wave * 16 + r) * ZC + ZC_GMV + 8 * lane);
        float gn[8], gb[8];
#pragma unroll
        for (int i = 0; i < 8; ++i) { gn[i] = ng[8 * lane + i]; gb[i] = nb[8 * lane + i]; }
#pragma unroll
        for (int r = 0; r < 16; ++r) { const int tk = wave * 16 + r; float x[8]; unpack8(raw[r], x); float s = 0.f;
#pragma unroll
            for (int i = 0; i < 8; ++i) { x[i] = gelu_tanh(x[i]); s += x[i]; }
            const float mean = wave_sum(s) * (1.f / 512.f); float ss = 0.f;
#pragma unroll
            for (int i = 0; i < 8; ++i) { x[i] -= mean; ss += x[i] * x[i]; }
            const float rstd = rsqrtf(wave_sum(ss) * (1.f / 512.f) + LN_EPS);
            if ((lane >> 4) == g) { const int cl = 8 * (lane & 15);
#pragma unroll
                for (int i = 0; i < 8; ++i) vT[(cl + i) * 136 + tk] = (unsigned short)f2bf(x[i] * rstd * gn[i] + gb[i]); } } }
    __syncthreads();
    {   const int c16 = lane & 15, g4 = lane >> 4, t = 16 * wave + c16, nks = ((16 * wave + 15) >> 5) + 1;
        bf16x8_t wf[4];
#pragma unroll
        for (int ks = 0; ks < 4; ++ks) { wf[ks] = (bf16x8_t){0, 0, 0, 0, 0, 0, 0, 0};
            if (ks < nks) { const float* wp = wsp + (size_t)t * 128 + 32 * ks + 8 * g4; const v4f a = *(const v4f*)wp, b = *(const v4f*)(wp + 4); const int s0 = 32 * ks + 8 * g4;
                const v4u w = (v4u){pk2(s0 <= t ? a.x : 0.f, s0 + 1 <= t ? a.y : 0.f), pk2(s0 + 2 <= t ? a.z : 0.f, s0 + 3 <= t ? a.w : 0.f), pk2(s0 + 4 <= t ? b.x : 0.f, s0 + 5 <= t ? b.y : 0.f), pk2(s0 + 6 <= t ? b.z : 0.f, s0 + 7 <= t ? b.w : 0.f)};
                wf[ks] = __builtin_bit_cast(bf16x8_t, w); } }
        pg8::f32x4 acc[8];
#pragma unroll
        for (int ct = 0; ct < 8; ++ct) acc[ct] = (pg8::f32x4){0.f, 0.f, 0.f, 0.f};
#pragma unroll
        for (int ks = 0; ks < 4; ++ks) { if (ks < nks) {
#pragma unroll
            for (int ct = 0; ct < 8; ++ct) acc[ct] = __builtin_amdgcn_mfma_f32_16x16x32_bf16(*(const LAS bf16x8_t*)(vT + (16 * ct + c16) * 136 + 32 * ks + 8 * g4), wf[ks], acc[ct], 0, 0, 0); } }
        const float bias = bsp[t]; v2u ur[8];
#pragma unroll
        for (int ct = 0; ct < 8; ++ct) ur[ct] = *(const v2u*)(Z + (tok0 + t) * ZC + ZC_GMU + g * 128 + 16 * ct + 4 * g4);
#pragma unroll
        for (int ct = 0; ct < 8; ++ct) { const float u0 = bflo(ur[ct].x), u1 = bfhi(ur[ct].x), u2 = bflo(ur[ct].y), u3 = bfhi(ur[ct].y);
            const float o0 = gelu_tanh(u0) * (acc[ct][0] + bias), o1 = gelu_tanh(u1) * (acc[ct][1] + bias), o2 = gelu_tanh(u2) * (acc[ct][2] + bias), o3 = gelu_tanh(u3) * (acc[ct][3] + bias);
#if MERGE_FP8
            *(unsigned*)((unsigned char*)(p.ws + WS_BR) + (tok0 + t) * BRW + 1 * BW + g * 128 + 16 * ct + 4 * g4) = pk4_f8(o0, o1, o2, o3, BRSC); }
#else
            *(v2u*)((bf16*)(p.ws + WS_BR) + (tok0 + t) * BRW + 1 * BW + g * 128 + 16 * ct + 4 * g4) = (v2u){pk2(o0, o1), pk2(o2, o3)}; }
#endif
    }
    __syncthreads();
}

__device__ __forceinline__ void vt_item(const Params& p, LAS unsigned char* lds, int item, int tid) {
    const int h = item & 3, n = item >> 2; const size_t t0 = (size_t)n * 64;
    const bf16* Z = (const bf16*)(p.ws + WS_Z); bf16* VT = (bf16*)(p.ws + WS_VT);
    LAS unsigned short* vs = (LAS unsigned short*)lds;
#pragma unroll
    for (int r = 0; r < 2; ++r) { const int idx = tid + 512 * r, tk = idx >> 4, c8 = idx & 15;
        *(LAS v4u*)(vs + tk * 136 + 8 * c8) = *(const v4u*)(Z + (t0 + tk) * ZC + ZC_SBV + h * 128 + 8 * c8); }
    __syncthreads();
    { const int d = tid >> 2, jq = tid & 3; unsigned w[8];
#pragma unroll
      for (int x = 0; x < 8; ++x) w[x] = (unsigned)vs[(16 * jq + 2 * x) * 136 + d] | ((unsigned)vs[(16 * jq + 2 * x + 1) * 136 + d] << 16);
      bf16* dst = VT + ((size_t)h * 128 + d) * T + t0 + 16 * jq;
      *(v4u*)dst = (v4u){w[0], w[1], w[2], w[3]}; *(v4u*)(dst + 8) = (v4u){w[4], w[5], w[6], w[7]}; }
    __syncthreads();
}
constexpr int KTP = 136, VTP = 72;
__device__ __forceinline__ void sb_unit(const Params& p, LAS unsigned char* lds, int unit, int tid, int wave, int lane) {
    const int h = unit >> 6, q0 = (unit & 63) * 128, g = lane >> 4, c = lane & 15; const int qrow = q0 + 16 * wave + c;
    const bf16* Z = (const bf16*)(p.ws + WS_Z); const bf16* VT = (const bf16*)(p.ws + WS_VT) + (size_t)h * 128 * T; bf16* BR0 = (bf16*)(p.ws + WS_BR);
    LAS unsigned short* Kt = (LAS unsigned short*)lds;
    LAS unsigned short* Vt = Kt + 2 * 64 * KTP;
    LAS int* flags = (LAS int*)(Vt + 2 * 128 * VTP);
    bf16x8_t qf[4];
#pragma unroll
    for (int ks = 0; ks < 4; ++ks) qf[ks] = *(const bf16x8_t*)(Z + (size_t)qrow * ZC + ZC_SBQ + h * 128 + 32 * ks + 8 * g);
    pg8::f32x4 acc[8];
#pragma unroll
    for (int dt = 0; dt < 8; ++dt) acc[dt] = (pg8::f32x4){0.f, 0.f, 0.f, 0.f};
    float racc = 0.f;
    v4u kr[2], vr[2];
    const int jt = (q0 >> 6) + 1;
#define SB_GLOAD(j_) do { _Pragma("unroll") for (int r = 0; r < 2; ++r) { const int idx = tid + 512 * r; \
        kr[r] = *(const v4u*)(Z + (size_t)(64 * (j_) + (idx >> 4)) * ZC + ZC_SBK + h * 128 + 8 * (idx & 15)); \
        vr[r] = *(const v4u*)(VT + (size_t)(idx >> 3) * T + 64 * (j_) + 8 * (idx & 7)); } } while (0)
#define SB_LWRITE(b_) do { _Pragma("unroll") for (int r = 0; r < 2; ++r) { const int idx = tid + 512 * r; \
        *(LAS v4u*)(Kt + (b_) * 64 * KTP + (idx >> 4) * KTP + 8 * (idx & 15)) = kr[r]; *(LAS v4u*)(Vt + (b_) * 128 * VTP + (idx >> 3) * VTP + 8 * (idx & 7)) = vr[r]; } } while (0)
    LDS_BAR();
    SB_GLOAD(jt); SB_LWRITE(0);
    LDS_BAR();
    for (int j = jt, it = 0; j >= 0; --j, ++it) {
        const int cur = it & 1;
        SB_GLOAD(j > 0 ? j - 1 : 0);
        const bool wdone = __all(racc > 104.f);
        if (64 * j < q0 + 16 * wave + 15 && !wdone) {
            const LAS unsigned short* Kc = Kt + cur * 64 * KTP; const LAS unsigned short* Vc = Vt + cur * 128 * VTP;
            pg8::f32x4 z[4];
#pragma unroll
            for (int s = 0; s < 4; ++s) { z[s] = (pg8::f32x4){0.f, 0.f, 0.f, 0.f};
#pragma unroll
                for (int ks = 0; ks < 4; ++ks) z[s] = __builtin_amdgcn_mfma_f32_16x16x32_bf16(*(const LAS bf16x8_t*)(Kc + (16 * s + c) * KTP + 32 * ks + 8 * g), qf[ks], z[s], 0, 0, 0); }
            float sp[4][4], t[4], xs[4]; bool mk[4][4];
#pragma unroll
            for (int s = 0; s < 4; ++s) { t[s] = 0.f;
#pragma unroll
                for (int r = 0; r < 4; ++r) { const int key = 64 * j + 16 * s + 4 * g + r; mk[s][r] = key < qrow; const float zz = z[s][r] * 0.08838834764831845f; z[s][r] = zz;
                    sp[s][r] = mk[s][r] ? softplusf_(zz) : 0.f; t[s] += sp[s][r]; } }
            float grand = 0.f, higher[4];
#pragma unroll
            for (int s = 3; s >= 0; --s) { float x = t[s]; float y = __shfl(x, lane + 16); x += (g < 3) ? y : 0.f; y = __shfl(x, lane + 32); x += (g < 2) ? y : 0.f;
                xs[s] = x - t[s];
                const float tot = __shfl(x, c); higher[s] = grand; grand += tot; }
            bf16x8_t pf[2];
#pragma unroll
            for (int s = 0; s < 4; ++s) { float a[4]; float e = 0.f;
#pragma unroll
                for (int r = 3; r >= 0; --r) { const float la = z[s][r] - sp[s][r] - (racc + higher[s] + xs[s] + e); a[r] = mk[s][r] ? __expf(la) : 0.f; e += sp[s][r]; }
                const unsigned w0 = pk2(a[0], a[1]), w1 = pk2(a[2], a[3]);
                if ((s & 1) == 0) { pf[s >> 1][0] = (short)(w0 & 0xffff); pf[s >> 1][1] = (short)(w0 >> 16); pf[s >> 1][2] = (short)(w1 & 0xffff); pf[s >> 1][3] = (short)(w1 >> 16); }
                else              { pf[s >> 1][4] = (short)(w0 & 0xffff); pf[s >> 1][5] = (short)(w0 >> 16); pf[s >> 1][6] = (short)(w1 & 0xffff); pf[s >> 1][7] = (short)(w1 >> 16); } }
            racc += grand;
#pragma unroll
            for (int dt = 0; dt < 8; ++dt)
#pragma unroll
                for (int k2 = 0; k2 < 2; ++k2) { const v2u lo = *(const LAS v2u*)(Vc + (16 * dt + c) * VTP + 32 * k2 + 4 * g), hi = *(const LAS v2u*)(Vc + (16 * dt + c) * VTP + 32 * k2 + 16 + 4 * g);
                    const v4u vv = (v4u){lo.x, lo.y, hi.x, hi.y};
                    acc[dt] = __builtin_amdgcn_mfma_f32_16x16x32_bf16(__builtin_bit_cast(bf16x8_t, vv), pf[k2], acc[dt], 0, 0, 0); }
        }
        const bool wd2 = __all(racc > 104.f);
        if (lane == 0) flags[cur * 8 + wave] = wd2 ? 1 : 0;
        SB_LWRITE(cur ^ 1);
        LDS_BAR();
        int alld = 1;
#pragma unroll
        for (int w = 0; w < 8; ++w) alld &= flags[cur * 8 + w];
        if (alld) break;
    }
#undef SB_GLOAD
#undef SB_LWRITE
#pragma unroll
#if MERGE_FP8
    for (int dt = 0; dt < 8; ++dt) *(unsigned*)((unsigned char*)BR0 + (size_t)qrow * BRW + h * 128 + 16 * dt + 4 * g) = pk4_f8(acc[dt][0], acc[dt][1], acc[dt][2], acc[dt][3], BRSC);
#else
    for (int dt = 0; dt < 8; ++dt) { v2u w; w.x = pk2(acc[dt][0], acc[dt][1]); w.y = pk2(acc[dt][2], acc[dt][3]); *(v2u*)(BR0 + (size_t)qrow * BRW + h * 128 + 16 * dt + 4 * g) = w; }
#endif
}

struct GateOrder {
    pg8::StaticOrder s; int pn0;
    __device__ __forceinline__ bool next(int i, pg8::Unit& u) const { if (!s.next(i, u)) return false; u.pn += pn0; return true; }
    __device__ __forceinline__ void a_ready(const pg8::Unit&) const {}
    __device__ __forceinline__ void done(const pg8::Unit&) const {}
};
constexpr int GATE_PN0 = ZC_GATE / 256, GATE_WGS = 128;
__device__ __forceinline__ void phase_mixers(const Params& p, int l, LAS unsigned char* lds, int wg, int G, int tid, int wave, int lane, const XcdBarrier& bar) {
#if defined(PROBE_SPLIT)
    if (wg < 16) gdn_seq2(p, lds, wg, tid, wave, lane); else if (wg < 36) ml_seq2(p, lds, wg - 16, tid, wave, lane);
    xcd_barrier(bar);
    const int w2 = wg, G2 = G;
#else
    if (wg < 16) { gdn_seq2(p, lds, wg, tid, wave, lane); return; }
    if (wg < 36) { ml_seq2(p, lds, wg - 16, tid, wave, lane); return; }
    const int w2 = wg - 36, G2 = G - 36;
#endif
    if (GATE_SPLIT && G == 256) {
        if (w2 < GATE_WGS) {
            for (int it = w2; it < 256; it += GATE_WGS) mixer_gmlp_item(p, l, lds, it, tid, wave, lane);
            for (int it = w2; it < 256; it += GATE_WGS) sb_unit(p, lds, it, tid, wave, lane);
            __syncthreads();
            pg8::Gemm g{(const bf16*)(p.ws + WS_XB), (const bf16*)(p.ws + WS_WIN), T, ZC, D / 2, D / 2, D / 2}; GateOrder S; S.s.init(T, ZC - ZC_GATE, GATE_WGS, w2); S.pn0 = GATE_PN0;
#if GATE_FP8
            EpiGate8 E{p.ws + WS_MTMP, 1.f / 64.f};
            pg8::gemm_phase<EpiGate8, GateOrder, true, true, true>(lds, g, S, E);
#else
            pg8::EpiBf16<0> E{(bf16*)(p.ws + WS_Z), ZC, nullptr, 0, 0, 1.f / 64.f};
            pg8::gemm_phase<pg8::EpiBf16<0>, GateOrder, true, true, true>(lds, g, S, E);
#endif
        } else { const int w3 = w2 - GATE_WGS, G3 = G2 - GATE_WGS; __syncthreads();
            phase_convert<1>(p, l, lds, w3 * 8 + wave, G3 * 8, wave, lane); }
        return; }
    for (int it = w2; it < 256; it += G2) mixer_gmlp_item(p, l, lds, it, tid, wave, lane);
    for (int it = w2; it < 256; it += G2) sb_unit(p, lds, it, tid, wave, lane);
#if !defined(PROBE_CONV0)
    __syncthreads();
    {
        constexpr int NIT1 = (NEX * 2 * (D / 64) * (ED / 32)) + (NEX * (ED / 64) * (D / 32));
        const int nheavy = (G2 < 256 && 2 * G2 >= 256) ? 256 - G2 : 0, per_wave = NIT1 / (G2 * 8);
        const int NA = (nheavy > 0 && per_wave > 2 * CONV_SKIP) ? (per_wave - CONV_SKIP) * (G2 * 8) : NIT1;
        phase_convert<1>(p, l, lds, w2 * 8 + wave, G2 * 8, wave, lane, false, 0, NA);
        if (NA < NIT1 && w2 >= nheavy) phase_convert<1>(p, l, lds, (w2 - nheavy) * 8 + wave, (G2 - nheavy) * 8, wave, lane, false, NA, NIT1); }
#endif
}

__device__ __forceinline__ void phase_post(const Params& p, int l, int gw, int NGW, int lane) {
    const bf16* Z = (const bf16*)(p.ws + WS_Z); const float* GO = (const float*)(p.ws + WS_GO); const float* HO = (const float*)(p.ws + WS_HO); const float* HDEN = (const float*)(p.ws + WS_HDEN);
    bf16* BR2 = (bf16*)(p.ws + WS_BR) + 2 * BW; bf16* BR3 = (bf16*)(p.ws + WS_BR) + 3 * BW;
    const float* gng = p.in[I_GDNNG] + l * 128; const float* mng = p.in[I_MLNG] + l * BW;
    for (int t = gw; t < T; t += NGW) {
        {   const v4f a0 = *(const v4f*)(GO + (size_t)t * BW + 8 * lane), a1 = *(const v4f*)(GO + (size_t)t * BW + 8 * lane + 4); float o[8] = {a0.x, a0.y, a0.z, a0.w, a1.x, a1.y, a1.z, a1.w}; float ss = 0.f;
#pragma unroll
            for (int i = 0; i < 8; ++i) ss += o[i] * o[i];
            const float r = rsqrtf(sum16(ss) * (1.f / 128.f) + LN_EPS);
            const v4u graw = *(const v4u*)(Z + (size_t)t * ZC + ZC_GDNG + 8 * lane); float gt[8]; unpack8(graw, gt);
#pragma unroll
            for (int i = 0; i < 8; ++i) o[i] = o[i] * r * gng[(8 * lane + i) & 127] * siluf_(gt[i]);
#if MERGE_FP8
            *(v2u*)((unsigned char*)(p.ws + WS_BR) + (size_t)t * BRW + 2 * BW + 8 * lane) = (v2u){pk4_f8(o[0], o[1], o[2], o[3], BRSC), pk4_f8(o[4], o[5], o[6], o[7], BRSC)}; }
#else
            v4u w; w.x = pk2(o[0], o[1]); w.y = pk2(o[2], o[3]); w.z = pk2(o[4], o[5]); w.w = pk2(o[6], o[7]); *(v4u*)(BR2 + (size_t)t * BRW + 8 * lane) = w; }
#endif
        {   const v4f a0 = *(const v4f*)(HO + (size_t)t * BW + 8 * lane), a1 = *(const v4f*)(HO + (size_t)t * BW + 8 * lane + 4); float o[8] = {a0.x, a0.y, a0.z, a0.w, a1.x, a1.y, a1.z, a1.w}; float ss = 0.f;
            const float dn = __builtin_amdgcn_rcpf(fmaxf(fabsf(HDEN[(size_t)t * 4 + (lane >> 4)]), 1.f));
#pragma unroll
            for (int i = 0; i < 8; ++i) { o[i] *= dn; ss += o[i] * o[i]; }
            const float r = rsqrtf(sum16(ss) * (1.f / 128.f) + LN_EPS);
            const v4u graw = *(const v4u*)(Z + (size_t)t * ZC + ZC_MLO + 8 * lane); float gt[8]; unpack8(graw, gt);
#pragma unroll
            for (int i = 0; i < 8; ++i) o[i] = o[i] * r * mng[8 * lane + i] * sigmoidf_(gt[i]);
#if MERGE_FP8
            *(v2u*)((unsigned char*)(p.ws + WS_BR) + (size_t)t * BRW + 3 * BW + 8 * lane) = (v2u){pk4_f8(o[0], o[1], o[2], o[3], BRSC), pk4_f8(o[4], o[5], o[6], o[7], BRSC)}; }
#else
            v4u w; w.x = pk2(o[0], o[1]); w.y = pk2(o[2], o[3]); w.z = pk2(o[4], o[5]); w.w = pk2(o[6], o[7]); *(v4u*)(BR3 + (size_t)t * BRW + 8 * lane) = w; }
#endif
    }
}

__device__ __forceinline__ void ln_row(const float* yrow, const float* g, const float* b, int lane, v4f (&v)[8]) {
    const v4f* yr = (const v4f*)yrow + lane; float s = 0.f;
#pragma unroll
    for (int j = 0; j < 8; ++j) { v[j] = yr[64 * j]; s += (v[j].x + v[j].y) + (v[j].z + v[j].w); }
    const float mean = wave_sum(s) * (1.f / D); float s2 = 0.f;
#pragma unroll
    for (int j = 0; j < 8; ++j) { v[j] = v[j] - mean; s2 += (v[j].x * v[j].x + v[j].y * v[j].y) + (v[j].z * v[j].z + v[j].w * v[j].w); }
    const float rstd = rsqrtf(wave_sum(s2) * (1.f / D) + LN_EPS);
#pragma unroll
    for (int j = 0; j < 8; ++j) { const v4f gg = ((const v4f*)g)[lane + 64 * j], bb = ((const v4f*)b)[lane + 64 * j]; v[j] = v[j] * rstd * gg + bb; }
}
constexpr int RT_XP = 2052;
constexpr int RT_TAB = 131072 + 1024;
__device__ __forceinline__ void phase_ln1_router(const Params& p, int l, LAS unsigned char* lds, int wg, int G, int wave, int lane, int cnt_shift = 0) {
    const bf16* Y = (const bf16*)(p.ws + WS_Y); bf16* X1 = (bf16*)(p.ws + WS_X1); bf16* X1B = (bf16*)(p.ws + WS_X1B); int* LIST = (int*)(p.ws + WS_LIST); float* WL = (float*)(p.ws + WS_WL); unsigned* SLOT = (unsigned*)(p.ws + WS_SLOT);
    unsigned* cnt = (unsigned*)(p.ws + WS_CTL) + CW_CNT + l * 4096 + cnt_shift;
    const float* g1 = p.in[I_LN1G] + (size_t)l * D; const float* b1 = p.in[I_LN1B] + (size_t)l * D;
    const float* wr = p.in[I_WR] + (size_t)l * D * NE; const float rbias = p.in[I_RB][l * NE + lane];
    LAS float* xt = (LAS float*)lds;
    LAS float* part = (LAS float*)lds;
    LAS unsigned char* selm = lds + RT_TAB; LAS unsigned char* rkm = selm + 4096; LAS float* wtm = (LAS float*)(rkm + 4096); LAS unsigned* basem = (LAS unsigned*)(wtm + 4096);
    const int n_l = lane & 15, kq = lane >> 4;
    int gi = 0;
    for (int tg = wg; tg < T / 16; tg += G, ++gi) {
        {   v4f va[8], vb[8]; const size_t m0 = (size_t)tg * 16 + 2 * wave;
#pragma unroll
            for (int j = 0; j < 8; ++j) { va[j] = ld4(Y, m0 * D + 4 * lane + 256 * j, true); vb[j] = ld4(Y, (m0 + 1) * D + 4 * lane + 256 * j, true); }
            float sa = 0.f, sb = 0.f;
#pragma unroll
            for (int j = 0; j < 8; ++j) { sa += (va[j].x + va[j].y) + (va[j].z + va[j].w); sb += (vb[j].x + vb[j].y) + (vb[j].z + vb[j].w); }
            const float ma = wave_sum(sa) * (1.f / D), mb = wave_sum(sb) * (1.f / D); float qa = 0.f, qb = 0.f;
#pragma unroll
            for (int j = 0; j < 8; ++j) { va[j] = va[j] - ma; vb[j] = vb[j] - mb; qa += (va[j].x * va[j].x + va[j].y * va[j].y) + (va[j].z * va[j].z + va[j].w * va[j].w); qb += (vb[j].x * vb[j].x + vb[j].y * vb[j].y) + (vb[j].z * vb[j].z + vb[j].w * vb[j].w); }
            const float ra = rsqrtf(wave_sum(qa) * (1.f / D) + LN_EPS), rb = rsqrtf(wave_sum(qb) * (1.f / D) + LN_EPS);
#pragma unroll
            for (int j = 0; j < 8; ++j) { const v4f gg = ((const v4f*)g1)[lane + 64 * j], bb = ((const v4f*)b1)[lane + 64 * j]; va[j] = va[j] * ra * gg + bb; vb[j] = vb[j] * rb * gg + bb; }
#pragma unroll
            for (int rr = 0; rr < 2; ++rr) { const size_t m = m0 + rr; v2u* xo = (v2u*)(X1 + m * D) + lane;
#pragma unroll
                for (int j = 0; j < 8; ++j) { const v4f v = rr ? vb[j] : va[j]; xo[64 * j] = (v2u){pk2(v.x, v.y), pk2(v.z, v.w)};
#if MOE_UP_FP8
                    { unsigned w = 0; w = __builtin_amdgcn_cvt_pk_fp8_f32(v.x, v.y, w, false); w = __builtin_amdgcn_cvt_pk_fp8_f32(v.z, v.w, w, true); ((unsigned*)((unsigned char*)X1B + m * D))[lane + 64 * j] = w; }
#else
                    { v2u o; o.x = pk2(v.x, v.y); o.y = pk2(v.z, v.w); ((v2u*)(X1B + m * D))[lane + 64 * j] = o; }
#endif
                    *(LAS v4f*)(xt + (2 * wave + rr) * RT_XP + 4 * lane + 256 * j) = v; } } }
        __syncthreads();
        {   pg8::f32x4 acc[4];
#pragma unroll
            for (int i = 0; i < 4; ++i) acc[i] = (pg8::f32x4){0.f, 0.f, 0.f, 0.f};
            const float* wb = wr + (size_t)(256 * wave + 4 * kq) * NE + 4 * n_l;
            const LAS float* xa = xt + n_l * RT_XP + 256 * wave + 4 * kq;
            v4f bwa[16], bwb[16];
#define RT_LOADW(dst, sb_) do { _Pragma("unroll") for (int q = 0; q < 16; ++q) dst[q] = *(const v4f*)(wb + (size_t)(16 * (4 * (sb_) + (q >> 2)) + (q & 3)) * NE); } while (0)
#define RT_MMA(src, sb_) do { _Pragma("unroll") for (int sg = 0; sg < 4; ++sg) { const v4f a4 = *(const LAS v4f*)(xa + 16 * (4 * (sb_) + sg)); \
                _Pragma("unroll") for (int c = 0; c < 4; ++c) { const v4f b4 = src[sg * 4 + c]; const float a = c == 0 ? a4.x : c == 1 ? a4.y : c == 2 ? a4.z : a4.w; \
                    acc[0] = __builtin_amdgcn_mfma_f32_16x16x4f32(a, b4.x, acc[0], 0, 0, 0); acc[1] = __builtin_amdgcn_mfma_f32_16x16x4f32(a, b4.y, acc[1], 0, 0, 0); \
                    acc[2] = __builtin_amdgcn_mfma_f32_16x16x4f32(a, b4.z, acc[2], 0, 0, 0); acc[3] = __builtin_amdgcn_mfma_f32_16x16x4f32(a, b4.w, acc[3], 0, 0, 0); } } } while (0)
            RT_LOADW(bwa, 0);
#pragma unroll 1
            for (int h = 0; h < 2; ++h) {
                RT_LOADW(bwb, 1); RT_MMA(bwa, 0);
                if (h == 0) RT_LOADW(bwa, 2);
                RT_MMA(bwb, 1);
                wb += (size_t)128 * NE; xa += 128; asm volatile("" : "+v"(wb));
            }
#undef RT_LOADW
#undef RT_MMA
            __syncthreads();
#pragma unroll
            for (int j = 0; j < 4; ++j) *(LAS v4f*)(part + (wave * 16 + 4 * kq + j) * 64 + 4 * n_l) = (v4f){acc[0][j], acc[1][j], acc[2][j], acc[3][j]}; }
        __syncthreads();
#pragma unroll 1
        for (int rr = 0; rr < 2; ++rr) { const int lr = wave + 8 * rr; float logit = 0.f;
#pragma unroll
            for (int w = 0; w < 8; ++w) logit += part[(w * 16 + lr) * 64 + lane];
            const float s = sigmoid_div(logit), biased = s + rbias;
            const float m1 = max8(biased); const float li = (float)(lane & 7);
            const float first = min8(biased == m1 ? li : 8.f);
            const float m2 = max8(li == first ? -INFINITY : biased);
            const float gs = m1 + m2; const int myg = lane >> 3; int grank = 0;
#pragma unroll
            for (int g2 = 0; g2 < 8; ++g2) { const float o = __builtin_bit_cast(float, __builtin_amdgcn_readlane(__builtin_bit_cast(int, gs), g2 * 8)); grank += (o > gs || (o == gs && g2 < myg)) ? 1 : 0; }
            const float masked = grank < 4 ? biased : -INFINITY; int rank = 0;
#pragma unroll 8
            for (int e2 = 0; e2 < 64; ++e2) { const float o = __builtin_bit_cast(float, __builtin_amdgcn_readlane(__builtin_bit_cast(int, masked), e2)); rank += (o > masked || (o == masked && e2 < lane)) ? 1 : 0; }
            const float wsel = rank < 6 ? s : 0.f; const float tot = wave_sum(wsel);
            const int ri = gi * 16 + lr;
            selm[ri * 64 + lane] = (rank < 6) ? 1 : 0; rkm[ri * 64 + lane] = (unsigned char)rank; wtm[ri * 64 + lane] = wsel / tot * 2.5f; }
        __syncthreads();
    }
    const int nrows = gi * 16;
    if (wave == 0) { unsigned n = 0;
        for (int r = 0; r < nrows; ++r) n += selm[r * 64 + lane];
        unsigned base = 0; if (n && !(PROBE_NOATOM && cnt_shift)) base = __hip_atomic_fetch_add(cnt + 64 * lane, n, __ATOMIC_RELAXED, __HIP_MEMORY_SCOPE_AGENT);
        basem[lane] = base; }
    __syncthreads();
    for (int ri = wave; ri < nrows; ri += 8) { unsigned pos = basem[lane];
        for (int r = 0; r < ri; ++r) pos += selm[r * 64 + lane];
        if (selm[ri * 64 + lane]) { const size_t m = (size_t)(wg + (ri >> 4) * G) * 16 + (ri & 15); const int rk = rkm[ri * 64 + lane];
            LIST[lane * T + pos] = (int)m; WL[lane * T + pos] = wtm[ri * 64 + lane]; SLOT[m * 8 + rk] = ((unsigned)lane << 16) | pos; } }
    __syncthreads();
}
__device__ __forceinline__ void phase_combine_ln2(const Params& p, int l, void* dst, bool dbf, int gw, int NGW, int lane) {
    const bf16* X1 = (const bf16*)(p.ws + WS_X1); const bf16* YE = (const bf16*)(p.ws + WS_YEXP); const unsigned* SLOT = (const unsigned*)(p.ws + WS_SLOT);
    const unsigned* cnt = (const unsigned*)(p.ws + WS_CTL) + CW_CNT + l * 4096;
    const float* g2 = p.in[I_LN2G] + (size_t)l * D; const float* b2 = p.in[I_LN2B] + (size_t)l * D;
    const int tiles = ((int)cnt[64 * lane] + 255) >> 8; const float incl = wave_scan_incl((float)tiles);
    const int toff = (int)incl - tiles;
    const int tsh = __builtin_amdgcn_readlane((int)incl, 63);
    for (int m = gw; m < T; m += NGW) {
        v4f v[8];
#pragma unroll
        for (int j = 0; j < 8; ++j) v[j] = ld4(X1, (size_t)m * D + 4 * lane + 256 * j, true) * ALPHA;
#pragma unroll
        for (int k = 0; k < 7; ++k) { size_t row;
            if (k == 0) row = (size_t)tsh * 256 + m;
            else { const unsigned s = __builtin_amdgcn_readfirstlane(SLOT[(size_t)m * 8 + (k - 1)]); const int e = (int)(s >> 16); row = (size_t)__builtin_amdgcn_readlane(toff, e) * 256 + (s & 0xffffu); }
#if YEXP_FP8
            const unsigned* yr = (const unsigned*)((const unsigned char*)YE + row * D) + lane;
#pragma unroll
            for (int j = 0; j < 8; ++j) { const unsigned y = yr[64 * j]; const auto lo = __builtin_amdgcn_cvt_pk_f32_fp8(y, false), hi = __builtin_amdgcn_cvt_pk_f32_fp8(y, true);
                v[j].x += lo[0] * (1.f / YSC); v[j].y += lo[1] * (1.f / YSC); v[j].z += hi[0] * (1.f / YSC); v[j].w += hi[1] * (1.f / YSC); } }
#else
            const v2u* yr = (const v2u*)(YE + row * D) + lane;
#pragma unroll
            for (int j = 0; j < 8; ++j) { const v2u y = yr[64 * j]; v[j].x += bflo(y.x); v[j].y += bfhi(y.x); v[j].z += bflo(y.y); v[j].w += bfhi(y.y); } }
#endif
        float s = 0.f;
#pragma unroll
        for (int j = 0; j < 8; ++j) s += (v[j].x + v[j].y) + (v[j].z + v[j].w);
        const float mean = wave_sum(s) * (1.f / D); float s2 = 0.f;
#pragma unroll
        for (int j = 0; j < 8; ++j) { v[j] = v[j] - mean; s2 += (v[j].x * v[j].x + v[j].y * v[j].y) + (v[j].z * v[j].z + v[j].w * v[j].w); }
        const float rstd = rsqrtf(wave_sum(s2) * (1.f / D) + LN_EPS);
#pragma unroll
        for (int j = 0; j < 8; ++j) { const v4f gg = ((const v4f*)g2)[lane + 64 * j], bb = ((const v4f*)b2)[lane + 64 * j]; const v4f o = v[j] * rstd * gg + bb;
            if (dbf) ((v2u*)((bf16*)dst + (size_t)m * D))[lane + 64 * j] = (v2u){pk2(o.x, o.y), pk2(o.z, o.w)};
            else ((v4f*)((float*)dst + (size_t)m * D))[lane + 64 * j] = o; }
    }
}

constexpr int NPH = 11;
template <class S> struct DupOrder {
    S s; int n;
    __device__ __forceinline__ bool next(int i, Unit& u) const { return s.next(i >= n ? i - n : i, u); }
    __device__ __forceinline__ int row_token(int i, int r) const { return s.row_token(i >= n ? i - n : i, r); }
    __device__ __forceinline__ void a_ready(const Unit& u) const { s.a_ready(u); }
    __device__ __forceinline__ void done(const Unit& u) const { s.done(u); }
};
template <class S> __device__ __forceinline__ int count_units(const S& s) { Unit u; int n = 0; while (n < 64 && s.next(n, u)) ++n; return n; }
#define ORDER_T(k, T) typename std::conditional<PROBE_DUP == (k), DupOrder<T>, T>::type
template <class S> __device__ __forceinline__ DupOrder<S> make_order(const S& s, std::true_type) { DupOrder<S> d{s, count_units(s)}; d.n = count_units(s); return d; }
template <class S> __device__ __forceinline__ S make_order(const S& s, std::false_type) { return s; }
#define MAKE_ORDER(k, s) make_order(s, std::integral_constant<bool, PROBE_DUP == (k)>())
template <int l>
__device__ __forceinline__ void run_layer(const Params& p, LAS unsigned char* lds, const XcdBarrier& bar, int tid, int lane, int wave, int G, int wg, int gw, int NGW) {
    unsigned char* ws = p.ws;
    {
        const void* xin = (l == 0) ? (const void*)p.in[I_X] : (const void*)(ws + WS_XCUR);
        void* xout = (l == NL - 1) ? (void*)p.out : (void*)(ws + WS_XCUR);
#ifndef PROBE_DUP
#define PROBE_DUP (-1)
#endif
#define IS_GEMM_PH(k) ((k) == 1 || (k) == 5 || (k) == 6 || (k) == 8 || (k) == 9)
#define REP(k) _Pragma("nounroll") for (int _r = 0; _r < ((PROBE_DUP == (k) && !IS_GEMM_PH(k)) ? 2 + (p.ph_lo >> 20) : 1); ++_r)
#ifndef PH_MASK
#define PH_MASK 0x7ff
#endif
#define RUN(k) (((PH_MASK >> (k)) & 1) && p.ph_lo <= l * NPH + (k) && l * NPH + (k) < p.ph_hi)
#define SEAM(k) do { if (l * NPH + (k) + 1 < p.ph_hi) xcd_barrier(bar); } while (0)
        if (RUN(0)) { REP(0) { phase_convert<0>(p, l, lds, gw, NGW, wave, lane);
#if defined(PROBE_CONV0)
            phase_convert<1>(p, l, lds, gw, NGW, wave, lane);
#endif
 phase_xprep(p, l, xin, l > 0, lds, gw, NGW, tid, lane); } SEAM(0); }
        if (RUN(1)) { REP(1) { pg8::Gemm g{(const bf16*)(ws + WS_XB), (const bf16*)(ws + WS_WIN), T, ZC, D / 2, D / 2, D / 2}; pg8::StaticOrder S; S.init(T, (GATE_SPLIT && G == 256) ? ZC_GATE : ZC, G, wg);
            pg8::EpiBf16<0> E{(bf16*)(ws + WS_Z), ZC, nullptr, 0, 0, 1.f / 64.f};
            auto S2 = MAKE_ORDER(1, S); pg8::gemm_phase<pg8::EpiBf16<0>, ORDER_T(1, pg8::StaticOrder), true, true, true>(lds, g, S2, E); } SEAM(1); }
        if (RUN(2)) { REP(2) { for (int it = wg; it < 1536; it += G) { if (it < 512) gdn_pre_item(p, l, lds, it, tid, wave, lane); else if (it < 1024) ml_pre_item(p, l, lds, it - 512, tid, wave, lane); else vt_item(p, lds, it - 1024, tid); } } SEAM(2); }
        if (RUN(3)) { REP(3) { phase_mixers(p, l, lds, wg, G, tid, wave, lane, bar); } SEAM(3); }
        if (RUN(4)) { REP(4) { phase_post(p, l, gw, NGW, lane); } SEAM(4); }
        if (RUN(5)) { REP(5) { constexpr int KM = MERGE_FP8 ? BRW / 2 : BRW; pg8::Gemm g{(const bf16*)(ws + WS_BR), (const bf16*)(ws + WS_WBR), T, D, KM, KM, KM}; pg8::StaticOrder S; S.init(T, D, G, wg);
            EpiMergeH E{(const bf16*)(ws + ((GATE_FP8 && GATE_SPLIT && G == 256) ? WS_MTMP : WS_Z)), (bf16*)(ws + WS_MSUM)};
            auto S2 = MAKE_ORDER(5, S); pg8::gemm_phase<EpiMergeH, ORDER_T(5, pg8::StaticOrder), true, true, MERGE_FP8 != 0>(lds, g, S2, E); } SEAM(5); }
        if (RUN(6)) { REP(6) { pg8::Gemm g{(const bf16*)(ws + WS_MSUM), (const bf16*)(ws + WS_WOUT), T, D, D / 2, D / 2, D / 2}; pg8::StaticOrder S; S.init(T, D, G, wg);
            EpiResid E{xin, (bf16*)(ws + WS_Y), 1.f / 64.f, l > 0};
            auto S2 = MAKE_ORDER(6, S); pg8::gemm_phase<EpiResid, ORDER_T(6, pg8::StaticOrder), true, true, true>(lds, g, S2, E); } SEAM(6); }
        if (RUN(7)) { REP(7) { phase_ln1_router(p, l, lds, wg, G, wave, lane, (PROBE_DUP == 7 && _r == 0) ? 16384 : 0); } SEAM(7); }
        if (RUN(8)) { REP(8) { const unsigned* cnt = (const unsigned*)(ws + WS_CTL) + CW_CNT + l * 4096; MoeTab M(lds); moe_tables(M, cnt, tid, lane, wave);
            UpOrder S{M, 0}; S.n = up_order_build(M, (const int*)(ws + WS_LIST), (const float*)(ws + WS_WL), wg, G, tid);
            constexpr int KU = MOE_UP_FP8 ? D / 2 : D;
            pg8::Gemm g{(const bf16*)(ws + WS_X1B), (const bf16*)(ws + WS_WUP), T, NEX * 1024, KU, KU, KU};
            EpiGluSparse E{(LAS const float*)M.wt, (bf16*)(ws + WS_HB)};
            auto S2 = MAKE_ORDER(8, S); pg8::gemm_phase_gather<EpiGluSparse, ORDER_T(8, UpOrder), MOE_UP_FP8 != 0>(lds, g, S2, E); } SEAM(8); }
        if (RUN(9)) { REP(9) { const unsigned* cnt = (const unsigned*)(ws + WS_CTL) + CW_CNT + l * 4096; MoeTab M(lds); moe_tables(M, cnt, tid, lane, wave);
            DownOrder S{M, G, wg, 8 * M.t[65]};
            constexpr int KD = MOE_DN_FP8 ? ED / 2 : ED;
            pg8::Gemm g{(const bf16*)(ws + WS_HB), (const bf16*)(ws + WS_WDN), HROWS, NEX * D, KD, KD, KD};
            EpiYexp E{(bf16*)(ws + WS_YEXP)};
            auto S2 = MAKE_ORDER(9, S); pg8::gemm_phase<EpiYexp, ORDER_T(9, DownOrder), true, true, MOE_DN_FP8 != 0>(lds, g, S2, E); } SEAM(9); }
        if (RUN(10)) { REP(10) { phase_combine_ln2(p, l, xout, l != NL - 1, gw, NGW, lane); } SEAM(10); }
#undef RUN
#undef SEAM
    }
}
__global__ void __launch_bounds__(512, 2) fwd_kernel(Params p) {
    extern __shared__ __attribute__((aligned(16))) unsigned char lds_raw[];
    LAS unsigned char* lds = (LAS unsigned char*)lds_raw;
    const int tid = threadIdx.x, lane = tid & 63, wave = __builtin_amdgcn_readfirstlane(tid >> 6);
    const int G = gridDim.x, wg = blockIdx.x, gw = wg * 8 + wave, NGW = G * 8;
    volatile LAS unsigned* MISC = (volatile LAS unsigned*)(lds + MISC_OFF);
    if (tid < 32) MISC[tid] = 0u;
    __syncthreads();
    unsigned* ctl = (unsigned*)(p.ws + WS_CTL);
    const bool multi = (p.ph_hi - p.ph_lo) > 1;
    XcdBarrier bar; bar.bar = ctl + CW_BAR; bar.x = 0; bar.st = nullptr;
    if (multi) bar = xcd_barrier_post(ctl + CW_BAR, MISC + 8);
    run_layer<0>(p, lds, bar, tid, lane, wave, G, wg, gw, NGW);
    run_layer<1>(p, lds, bar, tid, lane, wave, G, wg, gw, NGW);
}

#ifndef MK_MULTI_LAUNCH
#define MK_MULTI_LAUNCH 0
#endif
extern "C" void kernel_launch(void* const* d_in, const int* in_sizes, int n_in, void* d_out, int out_size, void* d_ws, size_t ws_size, hipStream_t stream) {
    static int grid = 0;
    if (grid == 0) {
        if (n_in != 27 || out_size != T * D || ws_size < WS_END) { fprintf(stderr, "kernel_launch: unexpected shapes (n_in %d out %d ws %zu need %zu)\n", n_in, out_size, ws_size, (size_t)WS_END); grid = -1; return; }
        int dev = 0, cus = 0, per_cu = 0;
        if (hipGetDevice(&dev) != hipSuccess || hipDeviceGetAttribute(&cus, hipDeviceAttributeMultiprocessorCount, dev) != hipSuccess) { grid = -1; return; }
        if (hipFuncSetAttribute((const void*)fwd_kernel, hipFuncAttributeMaxDynamicSharedMemorySize, LDS_BYTES) != hipSuccess) { fprintf(stderr, "kernel_launch: hipFuncSetAttribute failed\n"); grid = -1; return; }
        if (hipOccupancyMaxActiveBlocksPerMultiprocessor(&per_cu, (const void*)fwd_kernel, 512, LDS_BYTES) != hipSuccess || per_cu < 1) { fprintf(stderr, "kernel_launch: occupancy query says %d\n", per_cu); }
        (void)hipGetLastError();
        grid = cus;
        if (GATE_FP8 && GATE_SPLIT && cus != 256) { fprintf(stderr, "kernel_launch: this build's phase-3 role split assumes 256 CUs (have %d)\n", cus); grid = -1; return; }
    }
    if (grid < 0) return;
    (void)hipMemsetAsync((char*)d_ws + WS_CTL, 0, CTL_ZERO_BYTES, stream);
    Params p{};
    for (int i = 0; i < 27; ++i) p.in[i] = (const float*)d_in[i];
    p.out = (float*)d_out; p.ws = (unsigned char*)d_ws;
#if MK_MULTI_LAUNCH
    for (int ph = 0; ph < NL * NPH; ++ph) { p.ph_lo = ph; p.ph_hi = ph + 1; hipLaunchKernelGGL(fwd_kernel, dim3(grid), dim3(512), LDS_BYTES, stream, p); }
#else
    p.ph_lo = 0; p.ph_hi = NL * NPH; hipLaunchKernelGGL(fwd_kernel, dim3(grid), dim3(512), LDS_BYTES, stream, p);
#endif
}
```

```cpp
#include <hip/hip_runtime.h>
#include <cstdio>
#include <cstdint>
#include <type_traits>
namespace pg8 {
#define PG8_LAS __attribute__((address_space(3)))
typedef unsigned short bf16_t;
typedef short bf16x8 __attribute__((ext_vector_type(8)));
typedef float f32x4 __attribute__((ext_vector_type(4)));
typedef unsigned u32x4 __attribute__((ext_vector_type(4)));
constexpr int BM = 256, BK = 64, HALF = 128, HTB = HALF * BK * 2  , STAGE_BYTES = 8 * HTB, NXCD = 8, WGM = 8;

__host__ __device__ __forceinline__ int lds_byte(int r, int c) { const int st = (r >> 4) * 2 + (c >> 5), rr = r & 15, cc = c & 31, ob = rr * 64 + cc * 2; return st * 1024 + (ob ^ (((ob >> 9) & 1) << 5)); }
__host__ __device__ __forceinline__ void stage_rc(int b, int& R, int& C) { const int st = b / 1024, sb = b % 1024, swz = sb ^ (((sb >> 9) & 1) << 5); R = (st >> 1) * 16 + swz / 64; C = (st & 1) * 32 + (swz % 64) / 2; }
__host__ __device__ __forceinline__ int perm32(int rho) { const int n = rho >> 4, i = rho & 15; return 8 * (i >> 2) + 4 * n + (i & 3); }

struct Unit { int pm, pn, aux; };
struct Gemm { const bf16_t* A; const bf16_t* Bt; int M, N, K, lda, ldb; };

struct StaticOrder {
    int nM, nN, nwg, G, c;
    __host__ __device__ void init(int M, int N, int G_, int c_) { nM = M / BM; nN = N / BM; nwg = nM * nN; G = G_; c = c_; }
    __host__ __device__ bool next(int i, Unit& u) const {
        const long L = (long)i * G + c; if (L >= nwg) return false;
        int wgid = (int)L; { const int q = nwg / NXCD, r = nwg % NXCD, xcd = wgid % NXCD, off = wgid / NXCD; wgid = (xcd < r ? xcd * (q + 1) : r * (q + 1) + (xcd - r) * q) + off; }
        const int nig = WGM * nN, gid = wgid / nig, fm = gid * WGM, gsz = (nM - fm) < WGM ? (nM - fm) : WGM;
        u.pm = fm + ((wgid % nig) % gsz); u.pn = (wgid % nig) / gsz; return true;
    }
    __device__ __forceinline__ void a_ready(const Unit&) const {}
    __device__ __forceinline__ void done(const Unit&) const {}
};

__device__ __forceinline__ unsigned cvt_pk_bf16(float lo, float hi) { unsigned r; asm volatile("v_cvt_pk_bf16_f32 %0, %1, %2" : "=v"(r) : "v"(lo), "v"(hi)); return r; }
typedef float f32x2 __attribute__((ext_vector_type(2)));
__device__ __forceinline__ f32x2 gelu_pk(f32x2 v) {
    const f32x2 av = __builtin_elementwise_abs(v), d = av * 0.2316418882f + 1.0f;
    f32x2 t; t.x = __builtin_amdgcn_rcpf(d.x); t.y = __builtin_amdgcn_rcpf(d.y);
    f32x2 q = t * 0.5307027145f + (-0.7265760135f); q = q * t + 0.7107068705f; q = q * t + (-0.142248368f); q = q * t + 0.127414796f; q = q * t;
    const f32x2 s = (v * v) * (-0.72134752044f);
    f32x2 e; e.x = __builtin_amdgcn_exp2f(s.x); e.y = __builtin_amdgcn_exp2f(s.y);
    const f32x2 m = v * (q * e), r = v - m;
    f32x2 o; o.x = v.x < 0.f ? m.x : r.x; o.y = v.y < 0.f ? m.y : r.y; return o;
}

template <int ACT  > struct EpiBf16 {
    static constexpr bool PERM = true, AFTER_DRAIN = false; static constexpr int MID = 0; static_assert(ACT == 0 || ACT == 1, "EpiBf16: ACT is 0 (none) or 1 (gelu_pk)");
    bf16_t* O; int ldc; const float* bias; int split_cols; size_t split_stride; float scale0;
    __device__ __forceinline__ void operator()(const f32x4 (&acc)[2][2][4][2], const Unit& u, int wr, int wc, int fr, int fq) const {
        const int row0 = u.pm * BM + wr * 64 + fr; int colt = u.pn * BM; bf16_t* base = O;
        float sc = scale0; if (split_cols) { const int t = colt / split_cols; base += (size_t)t * split_stride; colt -= t * split_cols; if (t != 0) sc = 1.f; }
        const int col0 = colt + wc * 32 + 8 * fq, bcol0 = u.pn * BM + wc * 32 + 8 * fq;
        f32x4 bv[2][2];
#pragma unroll
        for (int bj = 0; bj < 2; ++bj)
#pragma unroll
            for (int n = 0; n < 2; ++n) bv[bj][n] = bias ? *(const f32x4*)(bias + bcol0 + bj * HALF + 4 * n) : (f32x4){0.f, 0.f, 0.f, 0.f};
#pragma unroll
        for (int ai = 0; ai < 2; ++ai)
#pragma unroll
            for (int m = 0; m < 4; ++m) { bf16_t* rowp = base + (size_t)(row0 + ai * HALF + m * 16) * ldc + col0;
#pragma unroll
                for (int bj = 0; bj < 2; ++bj) { f32x4 v0 = acc[ai][bj][m][0] + bv[bj][0], v1 = acc[ai][bj][m][1] + bv[bj][1];
                    if (ACT == 1) { f32x2 a = gelu_pk((f32x2){v0[0], v0[1]}), b = gelu_pk((f32x2){v0[2], v0[3]}), c = gelu_pk((f32x2){v1[0], v1[1]}), d = gelu_pk((f32x2){v1[2], v1[3]});
                        v0 = (f32x4){a.x, a.y, b.x, b.y}; v1 = (f32x4){c.x, c.y, d.x, d.y}; }
                    v0 = v0 * sc; v1 = v1 * sc; u32x4 w; w.x = cvt_pk_bf16(v0[0], v0[1]); w.y = cvt_pk_bf16(v0[2], v0[3]); w.z = cvt_pk_bf16(v1[0], v1[1]); w.w = cvt_pk_bf16(v1[2], v1[3]);
                    *(u32x4*)(rowp + bj * HALF) = w; } }
    }
};

typedef int i32x8 __attribute__((ext_vector_type(8)));
__device__ __forceinline__ i32x8 cat8(const bf16x8 a, const bf16x8 b) { typedef int i32x4 __attribute__((ext_vector_type(4))); const i32x4 x = __builtin_bit_cast(i32x4, a), y = __builtin_bit_cast(i32x4, b); return (i32x8){x[0], x[1], x[2], x[3], y[0], y[1], y[2], y[3]}; }
__device__ __forceinline__ bf16x8 lo8(const i32x8 v) { typedef int i32x4 __attribute__((ext_vector_type(4))); return __builtin_bit_cast(bf16x8, __builtin_shufflevector(v, v, 0, 1, 2, 3)); }
__device__ __forceinline__ bf16x8 hi8(const i32x8 v) { typedef int i32x4 __attribute__((ext_vector_type(4))); return __builtin_bit_cast(bf16x8, __builtin_shufflevector(v, v, 4, 5, 6, 7)); }
template <class Epi, class Sched, bool ALIGN_EPI = false, bool SP2 = false, bool FP8 = false>
__device__ __forceinline__ void gemm_phase(PG8_LAS unsigned char* lds, const Gemm g, const Sched& S, const Epi& E) {
    const int tid = threadIdx.x, wid = __builtin_amdgcn_readfirstlane(tid >> 6), lane = tid & 63, wr = wid >> 2, wc = wid & 3, fr = lane & 15, fq = lane >> 4;
    const int K = g.K, nt = K / BK;
    unsigned voffA[2], voffB[2];
#pragma unroll
    for (int i = 0; i < 2; ++i) { int R, C; stage_rc(tid * 16 + i * 8192, R, C); const int Rb = Epi::PERM ? ((R & ~31) + perm32(R & 31)) : R;
        voffA[i] = (unsigned)(R * g.lda + C) * 2u; voffB[i] = (unsigned)(Rb * g.ldb + C) * 2u; }
    const size_t kstep = (size_t)(BK * 2);
    const size_t hstepA = (size_t)HALF * g.lda * 2, hstepB = (size_t)HALF * g.ldb * 2;
    const size_t tstepA = 2 * hstepA, tstepB = 2 * hstepB;
    const unsigned ldsw = (unsigned)wid * 1024u;
    const int aoff = lds_byte(wr * 64 + fr, fq * 8), boff = lds_byte(wc * 32 + fr, fq * 8);
#define PG8_SA(b, h) (((b) * 2 + (h)) * HTB)
#define PG8_SB(b, h) ((4 + (b) * 2 + (h)) * HTB)
#define PG8_STAGE(bufoff, gbase, voff) do { _Pragma("unroll") for (int _i = 0; _i < 2; ++_i) \
        __builtin_amdgcn_global_load_lds((const unsigned*)((const char*)(gbase) + (voff)[_i]), (PG8_LAS unsigned*)(lds + (bufoff) + ldsw + _i * 8192), 16, 0, 0); } while (0)
#define PG8_LDA(dst, b, h) do { _Pragma("unroll") for (int m = 0; m < 4; ++m) { if constexpr (FP8) dst##8[m] = cat8(*(const PG8_LAS bf16x8*)(lds + PG8_SA(b, h) + aoff + m * 2048), *(const PG8_LAS bf16x8*)(lds + PG8_SA(b, h) + aoff + m * 2048 + 1024)); \
        else { _Pragma("unroll") for (int k = 0; k < 2; ++k) dst[m][k] = *(const PG8_LAS bf16x8*)(lds + PG8_SA(b, h) + aoff + m * 2048 + k * 1024); } } } while (0)
#define PG8_LDB(dst, b, h) do { _Pragma("unroll") for (int n = 0; n < 2; ++n) { if constexpr (FP8) dst##8[n] = cat8(*(const PG8_LAS bf16x8*)(lds + PG8_SB(b, h) + boff + n * 2048), *(const PG8_LAS bf16x8*)(lds + PG8_SB(b, h) + boff + n * 2048 + 1024)); \
        else { _Pragma("unroll") for (int k = 0; k < 2; ++k) dst[n][k] = *(const PG8_LAS bf16x8*)(lds + PG8_SB(b, h) + boff + n * 2048 + k * 1024); } } } while (0)
#define PG8_MMA(ai, bj, At, Bt) do { __builtin_amdgcn_s_setprio(1); _Pragma("unroll") for (int m = 0; m < 4; ++m) _Pragma("unroll") for (int n = 0; n < 2; ++n) { \
        if constexpr (FP8) asm volatile("v_mfma_scale_f32_16x16x128_f8f6f4 %0, %1, %2, %0, %3, %3 op_sel_hi:[0,0,0]" : "+v"(acc[ai][bj][m][n]) : "v"(Bt##8[n]), "v"(At##8[m]), "v"(fp8_unit_scale)); \
        else { _Pragma("unroll") for (int k = 0; k < 2; ++k) acc[ai][bj][m][n] = __builtin_amdgcn_mfma_f32_16x16x32_bf16(Bt[n][k], At[m][k], acc[ai][bj][m][n], 0, 0, 0); } } __builtin_amdgcn_s_setprio(0); } while (0)
#define PG8_WAIT_V(n) asm volatile("s_waitcnt vmcnt(" #n ")" ::: "memory")
#define PG8_WAIT_L(n) asm volatile("s_waitcnt lgkmcnt(" #n ")" ::: "memory")
#define PG8_BAR __builtin_amdgcn_s_barrier()
#define PG8_SCHED __builtin_amdgcn_sched_barrier(0)
    Unit cur, nxt; int ui = 0;
    if (!S.next(0, cur)) return;
    f32x4 acc[2][2][4][2];
#pragma unroll
    for (int a = 0; a < 2; ++a)
#pragma unroll
        for (int b = 0; b < 2; ++b)
#pragma unroll
            for (int m = 0; m < 4; ++m)
#pragma unroll
                for (int n = 0; n < 2; ++n) acc[a][b][m][n] = (f32x4){0.f, 0.f, 0.f, 0.f};
    int fp8_unit_scale = 0x7F7F7F7F; asm volatile("" : "+v"(fp8_unit_scale));
    bf16x8 At[4][2], B0[2][2], B1[2][2];
    i32x8 At8[4], B08[2], B18[2];
    const char* cA = (const char*)g.A + (size_t)cur.pm * tstepA; const char* cB = (const char*)g.Bt + (size_t)cur.pn * tstepB;
    S.a_ready(cur);
    if constexpr (SP2) {
        PG8_STAGE(PG8_SB(0, 0), cB, voffB); PG8_STAGE(PG8_SB(0, 1), cB + hstepB, voffB); PG8_STAGE(PG8_SA(0, 0), cA, voffA); PG8_STAGE(PG8_SA(0, 1), cA + hstepA, voffA);
        if (wr == 1) PG8_BAR;
        PG8_WAIT_V(2); PG8_BAR;
        PG8_STAGE(PG8_SB(1, 0), cB + kstep, voffB); PG8_STAGE(PG8_SA(1, 0), cA + kstep, voffA); PG8_STAGE(PG8_SB(1, 1), cB + hstepB + kstep, voffB);
        PG8_WAIT_V(6); PG8_BAR;
    } else {
        PG8_STAGE(PG8_SB(0, 0), cB, voffB); PG8_STAGE(PG8_SA(0, 0), cA, voffA); PG8_STAGE(PG8_SB(0, 1), cB + hstepB, voffB); PG8_STAGE(PG8_SA(0, 1), cA + hstepA, voffA);
        if (wr == 1) PG8_BAR;
        PG8_WAIT_V(4); PG8_BAR;
        PG8_STAGE(PG8_SB(1, 0), cB + kstep, voffB); PG8_STAGE(PG8_SA(1, 0), cA + kstep, voffA); PG8_STAGE(PG8_SB(1, 1), cB + hstepB + kstep, voffB);
        PG8_WAIT_V(6); PG8_BAR;
    }
    for (;;) {
        const bool has_next = S.next(ui + 1, nxt);
        const char* nA = has_next ? (const char*)g.A + (size_t)nxt.pm * tstepA : cA; const char* nB = has_next ? (const char*)g.Bt + (size_t)nxt.pn * tstepB : cB;
        for (int t = 0; t < nt; t += 2) {
            const bool last = (t == nt - 2);
            const char* a1 = cA + (size_t)(t + 1) * kstep;
            const char* a2 = last ? nA : cA + (size_t)(t + 2) * kstep; const char* b2 = last ? nB : cB + (size_t)(t + 2) * kstep;
            const char* a3 = a2 + kstep; const char* b3 = b2 + kstep;
            if (last && has_next) S.a_ready(nxt);
            if constexpr (SP2) {
            if constexpr (Epi::MID > 0) { if (t != 0 && (t % Epi::MID) == 0) { PG8_SCHED; if constexpr (FP8) asm volatile("s_nop 7\n\ts_nop 7" ::: "memory"); E.mid(acc, cur, t / Epi::MID, wr, wc, fr, fq); if constexpr (FP8) asm volatile("s_nop 7" ::: "memory"); PG8_SCHED; } }
            PG8_LDB(B0, 0, 0); PG8_LDB(B1, 0, 1); PG8_SCHED; PG8_LDA(At, 0, 0); PG8_STAGE(PG8_SA(1, 1), a1 + hstepA, voffA);
            PG8_WAIT_V(8); PG8_WAIT_L(0); PG8_BAR; PG8_MMA(0, 0, At, B0); PG8_MMA(0, 1, At, B1); PG8_BAR; PG8_SCHED;
            PG8_LDA(At, 0, 1); PG8_STAGE(PG8_SB(0, 0), b2, voffB); PG8_STAGE(PG8_SB(0, 1), b2 + hstepB, voffB); PG8_STAGE(PG8_SA(0, 0), a2, voffA);
            PG8_WAIT_V(8); PG8_WAIT_L(0); PG8_BAR; PG8_MMA(1, 0, At, B0); PG8_MMA(1, 1, At, B1); PG8_BAR; PG8_SCHED;
            PG8_LDB(B0, 1, 0); PG8_LDB(B1, 1, 1); PG8_SCHED; PG8_LDA(At, 1, 0); PG8_STAGE(PG8_SA(0, 1), a2 + hstepA, voffA);
            PG8_WAIT_V(8); PG8_WAIT_L(0); PG8_BAR; PG8_MMA(0, 0, At, B0); PG8_MMA(0, 1, At, B1); PG8_BAR; PG8_SCHED;
            PG8_LDA(At, 1, 1); PG8_STAGE(PG8_SB(1, 0), b3, voffB); PG8_STAGE(PG8_SB(1, 1), b3 + hstepB, voffB); PG8_STAGE(PG8_SA(1, 0), a3, voffA);
            PG8_WAIT_V(8); PG8_WAIT_L(0); PG8_BAR; PG8_MMA(1, 0, At, B0); PG8_MMA(1, 1, At, B1); PG8_BAR; PG8_SCHED;
            } else {
            PG8_LDB(B0, 0, 0); PG8_SCHED; PG8_LDA(At, 0, 0); PG8_STAGE(PG8_SA(1, 1), a1 + hstepA, voffA);
            PG8_WAIT_L(8); PG8_BAR; PG8_WAIT_L(0); PG8_MMA(0, 0, At, B0); PG8_BAR; PG8_SCHED;
            PG8_LDB(B1, 0, 1); PG8_STAGE(PG8_SB(0, 0), b2, voffB);
            PG8_BAR; PG8_WAIT_L(0); PG8_MMA(0, 1, At, B1); PG8_BAR;
            PG8_LDA(At, 0, 1); PG8_STAGE(PG8_SA(0, 0), a2, voffA);
            PG8_BAR; PG8_WAIT_L(0); PG8_MMA(1, 0, At, B0); PG8_BAR; PG8_SCHED;
            PG8_STAGE(PG8_SB(0, 1), b2 + hstepB, voffB);
            PG8_WAIT_V(6); PG8_BAR; PG8_MMA(1, 1, At, B1); PG8_BAR;
            PG8_LDB(B0, 1, 0); PG8_SCHED; PG8_LDA(At, 1, 0); PG8_STAGE(PG8_SA(0, 1), a2 + hstepA, voffA);
            PG8_WAIT_L(8); PG8_BAR; PG8_WAIT_L(0); PG8_MMA(0, 0, At, B0); PG8_BAR; PG8_SCHED;
            PG8_LDB(B1, 1, 1); PG8_STAGE(PG8_SB(1, 0), b3, voffB);
            PG8_BAR; PG8_WAIT_L(0); PG8_MMA(0, 1, At, B1); PG8_BAR;
            PG8_LDA(At, 1, 1); PG8_STAGE(PG8_SA(1, 0), a3, voffA);
            PG8_BAR; PG8_WAIT_L(0); PG8_MMA(1, 0, At, B0); PG8_BAR; PG8_SCHED;
            PG8_STAGE(PG8_SB(1, 1), b3 + hstepB, voffB);
            PG8_WAIT_V(6); PG8_BAR; PG8_MMA(1, 1, At, B1); PG8_BAR;
            }
        }
        if constexpr (ALIGN_EPI) { if (wr == 0) PG8_BAR; }
        if constexpr (FP8) asm volatile("s_nop 7\n\ts_nop 7" ::: "memory");
        if constexpr (!Epi::AFTER_DRAIN) { E(acc, cur, wr, wc, fr, fq); S.done(cur); }
        if (!has_next) break;
#pragma unroll
        for (int a = 0; a < 2; ++a)
#pragma unroll
            for (int b = 0; b < 2; ++b)
#pragma unroll
                for (int m = 0; m < 4; ++m)
#pragma unroll
                    for (int n = 0; n < 2; ++n) acc[a][b][m][n] = (f32x4){0.f, 0.f, 0.f, 0.f};
        cur = nxt; cA = nA; cB = nB; ++ui;
        if constexpr (ALIGN_EPI) { if (wr == 1) PG8_BAR; }
    }
    PG8_WAIT_V(0);
    if constexpr (!ALIGN_EPI) { if (wr == 0) PG8_BAR; }
    PG8_BAR;
    if constexpr (Epi::AFTER_DRAIN) { E.fused(acc, cur, wr, wc, fr, fq, lds, wid, lane); S.done(cur); }
#undef PG8_SA
#undef PG8_SB
#undef PG8_STAGE
#undef PG8_LDA
#undef PG8_LDB
#undef PG8_MMA
#undef PG8_WAIT_V
#undef PG8_WAIT_L
#undef PG8_BAR
#undef PG8_SCHED
}
template <class Epi, class Sched, bool FP8 = false>
__device__ __forceinline__ void gemm_phase_gather(PG8_LAS unsigned char* lds, const Gemm g, const Sched& S, const Epi& E) {
    const int tid = threadIdx.x, wid = __builtin_amdgcn_readfirstlane(tid >> 6), lane = tid & 63, wr = wid >> 2, wc = wid & 3, fr = lane & 15, fq = lane >> 4;
    const int K = g.K, nt = K / BK;
    unsigned voffB[2]; int RA[2], CA[2];
#pragma unroll
    for (int i = 0; i < 2; ++i) { int R, C; stage_rc(tid * 16 + i * 8192, R, C); const int Rb = Epi::PERM ? ((R & ~31) + perm32(R & 31)) : R;
        RA[i] = R; CA[i] = C; voffB[i] = (unsigned)(Rb * g.ldb + C) * 2u; }
    const size_t kstep = (size_t)(BK * 2);
    const size_t hstepB = (size_t)HALF * g.ldb * 2, tstepB = 2 * hstepB;
    const unsigned ldsw = (unsigned)wid * 1024u;
    const int aoff = lds_byte(wr * 64 + fr, fq * 8), boff = lds_byte(wc * 32 + fr, fq * 8);
#define PG8_SA(b, h) (((b) * 2 + (h)) * HTB)
#define PG8_SB(b, h) ((4 + (b) * 2 + (h)) * HTB)
#define PG8_STAGE(bufoff, gbase, voff) do { _Pragma("unroll") for (int _i = 0; _i < 2; ++_i) \
        __builtin_amdgcn_global_load_lds((const unsigned*)((const char*)(gbase) + (voff)[_i]), (PG8_LAS unsigned*)(lds + (bufoff) + ldsw + _i * 8192), 16, 0, 0); } while (0)
#define PG8_LDA(dst, b, h) do { _Pragma("unroll") for (int m = 0; m < 4; ++m) { if constexpr (FP8) dst##8[m] = cat8(*(const PG8_LAS bf16x8*)(lds + PG8_SA(b, h) + aoff + m * 2048), *(const PG8_LAS bf16x8*)(lds + PG8_SA(b, h) + aoff + m * 2048 + 1024)); \
        else { _Pragma("unroll") for (int k = 0; k < 2; ++k) dst[m][k] = *(const PG8_LAS bf16x8*)(lds + PG8_SA(b, h) + aoff + m * 2048 + k * 1024); } } } while (0)
#define PG8_LDB(dst, b, h) do { _Pragma("unroll") for (int n = 0; n < 2; ++n) { if constexpr (FP8) dst##8[n] = cat8(*(const PG8_LAS bf16x8*)(lds + PG8_SB(b, h) + boff + n * 2048), *(const PG8_LAS bf16x8*)(lds + PG8_SB(b, h) + boff + n * 2048 + 1024)); \
        else { _Pragma("unroll") for (int k = 0; k < 2; ++k) dst[n][k] = *(const PG8_LAS bf16x8*)(lds + PG8_SB(b, h) + boff + n * 2048 + k * 1024); } } } while (0)
#define PG8_MMA(ai, bj, At, Bt) do { __builtin_amdgcn_s_setprio(1); _Pragma("unroll") for (int m = 0; m < 4; ++m) _Pragma("unroll") for (int n = 0; n < 2; ++n) { \
        if constexpr (FP8) asm volatile("v_mfma_scale_f32_16x16x128_f8f6f4 %0, %1, %2, %0, %3, %3 op_sel_hi:[0,0,0]" : "+v"(acc[ai][bj][m][n]) : "v"(Bt##8[n]), "v"(At##8[m]), "v"(fp8_unit_scale)); \
        else { _Pragma("unroll") for (int k = 0; k < 2; ++k) acc[ai][bj][m][n] = __builtin_amdgcn_mfma_f32_16x16x32_bf16(Bt[n][k], At[m][k], acc[ai][bj][m][n], 0, 0, 0); } } __builtin_amdgcn_s_setprio(0); } while (0)
#define PG8_WAIT_V(n) asm volatile("s_waitcnt vmcnt(" #n ")" ::: "memory")
#define PG8_WAIT_L(n) asm volatile("s_waitcnt lgkmcnt(" #n ")" ::: "memory")
#define PG8_BAR __builtin_amdgcn_s_barrier()
#define PG8_SCHED __builtin_amdgcn_sched_barrier(0)
#define PG8_ROWS(dst, ui_) do { _Pragma("unroll") for (int _h = 0; _h < 2; ++_h) _Pragma("unroll") for (int _i = 0; _i < 2; ++_i) \
        dst[_h][_i] = (unsigned)S.row_token((ui_), _h * HALF + RA[_i]) * (unsigned)(g.lda * 2) + (unsigned)(CA[_i] * 2); } while (0)
    Unit cur, nxt; int ui = 0;
    if (!S.next(0, cur)) return;
    f32x4 acc[2][2][4][2];
#pragma unroll
    for (int a = 0; a < 2; ++a)
#pragma unroll
        for (int b = 0; b < 2; ++b)
#pragma unroll
            for (int m = 0; m < 4; ++m)
#pragma unroll
                for (int n = 0; n < 2; ++n) acc[a][b][m][n] = (f32x4){0.f, 0.f, 0.f, 0.f};
    int fp8_unit_scale = 0x7F7F7F7F; asm volatile("" : "+v"(fp8_unit_scale));
    bf16x8 At[4][2], B0[2][2], B1[2][2];
    i32x8 At8[4], B08[2], B18[2];
    unsigned offC[2][2];
    PG8_ROWS(offC, 0);
    const char* gA = (const char*)g.A;
    const char* cB = (const char*)g.Bt + (size_t)cur.pn * tstepB;
    PG8_STAGE(PG8_SB(0, 0), cB, voffB); PG8_STAGE(PG8_SB(0, 1), cB + hstepB, voffB); PG8_STAGE(PG8_SA(0, 0), gA, offC[0]); PG8_STAGE(PG8_SA(0, 1), gA, offC[1]);
    if (wr == 1) PG8_BAR;
    PG8_WAIT_V(2); PG8_BAR;
    PG8_STAGE(PG8_SB(1, 0), cB + kstep, voffB); PG8_STAGE(PG8_SA(1, 0), gA + kstep, offC[0]); PG8_STAGE(PG8_SB(1, 1), cB + hstepB + kstep, voffB);
    PG8_WAIT_V(6); PG8_BAR;
    for (;;) {
        const bool has_next = S.next(ui + 1, nxt);
        const char* nB = has_next ? (const char*)g.Bt + (size_t)nxt.pn * tstepB : cB;
        for (int t = 0; t < nt; t += 2) {
            const bool last = (t == nt - 2);
            const char* a1 = gA + (size_t)(t + 1) * kstep;
            const char* a2 = last ? gA : gA + (size_t)(t + 2) * kstep; const char* b2 = last ? nB : cB + (size_t)(t + 2) * kstep;
            const char* a3 = a2 + kstep; const char* b3 = b2 + kstep;
            PG8_LDB(B0, 0, 0); PG8_LDB(B1, 0, 1); PG8_SCHED; PG8_LDA(At, 0, 0); PG8_STAGE(PG8_SA(1, 1), a1, offC[1]);
            if (last && has_next) { PG8_ROWS(offC, ui + 1); }
            PG8_WAIT_V(8); PG8_WAIT_L(0); PG8_BAR; PG8_MMA(0, 0, At, B0); PG8_MMA(0, 1, At, B1); PG8_BAR; PG8_SCHED;
            PG8_LDA(At, 0, 1); PG8_STAGE(PG8_SB(0, 0), b2, voffB); PG8_STAGE(PG8_SB(0, 1), b2 + hstepB, voffB); PG8_STAGE(PG8_SA(0, 0), a2, offC[0]);
            PG8_WAIT_V(8); PG8_WAIT_L(0); PG8_BAR; PG8_MMA(1, 0, At, B0); PG8_MMA(1, 1, At, B1); PG8_BAR; PG8_SCHED;
            PG8_LDB(B0, 1, 0); PG8_LDB(B1, 1, 1); PG8_SCHED; PG8_LDA(At, 1, 0); PG8_STAGE(PG8_SA(0, 1), a2, offC[1]);
            PG8_WAIT_V(8); PG8_WAIT_L(0); PG8_BAR; PG8_MMA(0, 0, At, B0); PG8_MMA(0, 1, At, B1); PG8_BAR; PG8_SCHED;
            PG8_LDA(At, 1, 1); PG8_STAGE(PG8_SB(1, 0), b3, voffB); PG8_STAGE(PG8_SB(1, 1), b3 + hstepB, voffB); PG8_STAGE(PG8_SA(1, 0), a3, offC[0]);
            PG8_WAIT_V(8); PG8_WAIT_L(0); PG8_BAR; PG8_MMA(1, 0, At, B0); PG8_MMA(1, 1, At, B1); PG8_BAR; PG8_SCHED;
        }
        if (wr == 0) PG8_BAR;
        if constexpr (FP8) asm volatile("s_nop 7\n\ts_nop 7" ::: "memory");
        E(acc, cur, wr, wc, fr, fq); S.done(cur);
        if (!has_next) break;
#pragma unroll
        for (int a = 0; a < 2; ++a)
#pragma unroll
            for (int b = 0; b < 2; ++b)
#pragma unroll
                for (int m = 0; m < 4; ++m)
#pragma unroll
                    for (int n = 0; n < 2; ++n) acc[a][b][m][n] = (f32x4){0.f, 0.f, 0.f, 0.f};
        cur = nxt; cB = nB; ++ui;
        if (wr == 1) PG8_BAR;
    }
    PG8_WAIT_V(0);
    PG8_BAR;
#undef PG8_ROWS
#undef PG8_SA
#undef PG8_SB
#undef PG8_STAGE
#undef PG8_LDA
#undef PG8_LDB
#undef PG8_MMA
#undef PG8_WAIT_V
#undef PG8_WAIT_L
#undef PG8_BAR
#undef PG8_SCHED
}
}

#ifndef GATE_FP8
#define GATE_FP8 1
#endif
#ifndef GATE_SPLIT
#define GATE_SPLIT 1
#endif
#ifndef YEXP_FP8
#define YEXP_FP8 1
#endif
#ifndef CONV_SKIP
#define CONV_SKIP 6
#endif
#ifndef MERGE_FP8
#define MERGE_FP8 1
#endif
#ifndef MOE_DN_FP8
#define MOE_DN_FP8 1
#endif
#ifndef MOE_UP_FP8
#define MOE_UP_FP8 1
#endif
#ifndef PROBE_NOATOM
#define PROBE_NOATOM 0
#endif
constexpr int T = 8192, D = 2048, NL = 2, BW = 512, ZC = 14336, INC = 14352;
constexpr int NE = 64, NEX = 65  , ED = 512;
constexpr int BRW = 4 * BW;
constexpr int HK = NEX * ED;
constexpr float ALPHA = 1.41421356237f;
constexpr float LN_EPS = 1e-5f;
constexpr float UPSC = MOE_UP_FP8 ? (1.f / 64.f) : 1.f;
constexpr float BRSC = MERGE_FP8 ? 8.f : 1.f, MGSC = MERGE_FP8 ? (1.f / (8.f * 64.f)) : 1.f;
constexpr float GSC = 8.f;
constexpr float YSC = 64.f;
constexpr float HSC = 8.f, DNSC = MOE_DN_FP8 ? (1.f / (HSC * 64.f)) : 1.f;
constexpr int ZC_SBQ = 0, ZC_SBK = 512, ZC_SBV = 1024, ZC_GMU = 1536, ZC_GMV = 2048, ZC_GDN = 2560, ZC_GDNG = 4096,
              ZC_MLQ = 4608, ZC_MLK = 4864, ZC_MLV = 5120, ZC_MLO = 5632, ZC_GATE = 6144;

#define GAS __attribute__((address_space(1)))
#define LAS __attribute__((address_space(3)))
typedef unsigned short bf16;
typedef unsigned v4u __attribute__((ext_vector_type(4)));
typedef unsigned v2u __attribute__((ext_vector_type(2)));
typedef float v4f __attribute__((ext_vector_type(4)));
typedef float v2f __attribute__((ext_vector_type(2)));
#define LDS_WAIT() asm volatile("s_waitcnt lgkmcnt(0)" ::: "memory")
#define LDS_BAR() do { asm volatile("s_waitcnt lgkmcnt(0)" ::: "memory"); __builtin_amdgcn_s_barrier(); asm volatile("" ::: "memory"); } while (0)

constexpr size_t MiB = 1u << 20;
constexpr size_t WS_CTL = 0, CTL_ZERO_BYTES = 1 * MiB;
constexpr size_t WS_WIN = 2 * MiB, WS_WBR = 58 * MiB, WS_WOUT = 66 * MiB, WS_WUP = 74 * MiB, WS_WDN = 334 * MiB;
constexpr size_t WS_XB = 464 * MiB, WS_SMALL = 496 * MiB, WS_EG = 497 * MiB, WS_BETA = WS_EG + 256 * 1024, WS_COMB = 498 * MiB;
constexpr size_t WS_Z = 500 * MiB, WS_GQ = 724 * MiB, WS_GK = 740 * MiB, WS_GV = 756 * MiB, WS_GO = 772 * MiB, WS_HO = 788 * MiB;
constexpr size_t WS_BR = 804 * MiB, WS_MTMP = 836 * MiB, WS_MSUM = 900 * MiB, WS_Y = 932 * MiB, WS_X1 = 996 * MiB, WS_X1B = 1060 * MiB;
constexpr size_t WS_XCUR = 1092 * MiB, WS_HB = 1156 * MiB, WS_YEXP = 1236 * MiB, WS_LIST = 1524 * MiB, WS_WL = 1526 * MiB, WS_SLOT = 1528 * MiB, WS_MQ = 1530 * MiB, WS_MS = 1534 * MiB, WS_MK = 1538 * MiB, WS_MV = 1542 * MiB, WS_MFL = 1552 * MiB, WS_HDEN = WS_MFL + 65536, WS_VT = 1553 * MiB, WS_END = 1561 * MiB;
constexpr size_t WS_GU = WS_GQ, WS_GNW = WS_GK, WS_GQG = WS_GK + 8 * MiB, WS_GKT = WS_GV, WS_GAT = WS_GV + 8 * MiB, WS_GDL = WS_GV + 12 * MiB;
constexpr int HROWS = 73728;
static_assert(WS_HB + (size_t)HROWS * ED * 2 <= WS_YEXP && WS_YEXP + (size_t)HROWS * D * 2 <= WS_LIST, "ws map (moe)");
static_assert(WS_WIN + (size_t)ZC * D * 2 <= WS_WBR && WS_WUP + (size_t)NEX * 1024 * D * 2 <= WS_WDN && WS_WDN + (size_t)D * HK * 2 <= WS_XB, "ws map (weights)");
static_assert(WS_Z + (size_t)T * ZC * 2 <= WS_GQ, "ws map (acts)");
constexpr int CW_BAR = 4096, CW_CNT = 16384;
constexpr int TAB_OFF = 131072 + 1024;
constexpr int LDS_BYTES = 163840, MISC_OFF = 131072 + 320;

__device__ __forceinline__ float bflo(unsigned w) { return __uint_as_float(w << 16); }
__device__ __forceinline__ float bfhi(unsigned w) { return __uint_as_float(w & 0xffff0000u); }
__device__ __forceinline__ unsigned f2bf(float f) { unsigned u = __float_as_uint(f); return (u + 0x7fffu + ((u >> 16) & 1u)) >> 16; }
typedef __bf16 bf16n2 __attribute__((ext_vector_type(2))); typedef float f32n2 __attribute__((ext_vector_type(2)));
__device__ __forceinline__ unsigned pk2(float lo, float hi) { const bf16n2 v = __builtin_convertvector((f32n2){lo, hi}, bf16n2); return __builtin_bit_cast(unsigned, v); }
__device__ __forceinline__ unsigned pk4_f8(float a, float b, float c, float d, float sc) {
    a = __builtin_amdgcn_fmed3f(a * sc, -448.f, 448.f); b = __builtin_amdgcn_fmed3f(b * sc, -448.f, 448.f); c = __builtin_amdgcn_fmed3f(c * sc, -448.f, 448.f); d = __builtin_amdgcn_fmed3f(d * sc, -448.f, 448.f);
    unsigned w = 0; w = __builtin_amdgcn_cvt_pk_fp8_f32(a, b, w, false); w = __builtin_amdgcn_cvt_pk_fp8_f32(c, d, w, true); return w; }
__device__ __forceinline__ v4f ld4(const void* base, size_t idx, bool is_bf16) {
    if (is_bf16) { const v2u r = *(const v2u*)((const unsigned short*)base + idx); return (v4f){bflo(r.x), bfhi(r.x), bflo(r.y), bfhi(r.y)}; }
    return *(const v4f*)((const float*)base + idx); }
template <int CTRL> __device__ __forceinline__ float dpp(float x) { return __builtin_bit_cast(float, __builtin_amdgcn_mov_dpp(__builtin_bit_cast(int, x), CTRL, 0xf, 0xf, true)); }
__device__ __forceinline__ float sum4(float x) { x += dpp<0xB1>(x); x += dpp<0x4E>(x); return x; }
__device__ __forceinline__ float sum8(float x) { x = sum4(x); x += dpp<0x141>(x); return x; }
__device__ __forceinline__ float sum16(float x) { x = sum8(x); x += dpp<0x140>(x); return x; }
__device__ __forceinline__ float wave_sum(float x) { x = sum16(x); x += __shfl_xor(x, 16); x += __shfl_xor(x, 32); return x; }
__device__ __forceinline__ float max8(float x) { x = fmaxf(x, dpp<0xB1>(x)); x = fmaxf(x, dpp<0x4E>(x)); x = fmaxf(x, dpp<0x141>(x)); return x; }
__device__ __forceinline__ float min8(float x) { x = fminf(x, dpp<0xB1>(x)); x = fminf(x, dpp<0x4E>(x)); x = fminf(x, dpp<0x141>(x)); return x; }
__device__ __forceinline__ float wave_scan_incl(float v) {
    v += __builtin_bit_cast(float, __builtin_amdgcn_update_dpp(0, __builtin_bit_cast(int, v), 0x111, 0xf, 0xf, true));
    v += __builtin_bit_cast(float, __builtin_amdgcn_update_dpp(0, __builtin_bit_cast(int, v), 0x112, 0xf, 0xf, true));
    v += __builtin_bit_cast(float, __builtin_amdgcn_update_dpp(0, __builtin_bit_cast(int, v), 0x114, 0xf, 0xf, true));
    v += __builtin_bit_cast(float, __builtin_amdgcn_update_dpp(0, __builtin_bit_cast(int, v), 0x118, 0xf, 0xf, true));
    v += __builtin_bit_cast(float, __builtin_amdgcn_update_dpp(0, __builtin_bit_cast(int, v), 0x142, 0xa, 0xf, false));
    v += __builtin_bit_cast(float, __builtin_amdgcn_update_dpp(0, __builtin_bit_cast(int, v), 0x143, 0xc, 0xf, false));
    return v;
}
__device__ __forceinline__ float sigmoidf_(float x) { return __builtin_amdgcn_rcpf(1.f + __expf(-x)); }
__device__ __forceinline__ float sigmoid_div(float x) { return 1.f / (1.f + __expf(-x)); }
__device__ __forceinline__ float siluf_(float x) { return x * __builtin_amdgcn_rcpf(1.f + __expf(-x)); }
__device__ __forceinline__ float softplusf_(float x) { return fmaxf(x, 0.f) + __logf(1.f + __expf(-fabsf(x))); }
__device__ __forceinline__ float gelu_tanh(float x) { const float y = 0.7978845608f * (x + 0.044715f * x * x * x); const float t = 1.f - 2.f * __builtin_amdgcn_rcpf(__expf(2.f * y) + 1.f); return 0.5f * x * (1.f + t); }
__device__ __forceinline__ void unpack8(const v4u r, float (&f)[8]) { f[0] = bflo(r.x); f[1] = bfhi(r.x); f[2] = bflo(r.y); f[3] = bfhi(r.y); f[4] = bflo(r.z); f[5] = bfhi(r.z); f[6] = bflo(r.w); f[7] = bfhi(r.w); }
#define XB_TMO      128
#define XB_XCNT(j)  (256  + 64 * (j))
#define XB_XSUB(j)  (1280 + 64 * (j))
#define XB_XGEN(j)  (2304 + 64 * (j))
#define XB_TOP      3328
#define XB_TOPGEN   3392
#define XCD_BAR_WORDS 3456
#define XB_SPIN_CAP (1u << 18)

__device__ __forceinline__ unsigned xb_ld(unsigned* p)              { return __hip_atomic_load(p, __ATOMIC_RELAXED, __HIP_MEMORY_SCOPE_AGENT); }
__device__ __forceinline__ unsigned xb_add(unsigned* p, unsigned v) { return __hip_atomic_fetch_add(p, v, __ATOMIC_RELAXED, __HIP_MEMORY_SCOPE_AGENT); }
__device__ __forceinline__ unsigned xb_xcc_id() { return (unsigned)__builtin_amdgcn_s_getreg((3 << 11) | 20) & 0xFu; }
#define XB_SPIN(cond, bar) do { unsigned _sp = 0; while (cond) { __builtin_amdgcn_s_sleep(1); \
    if ((++_sp & 255u) == 0u) { if (xb_ld(&(bar)[XB_TMO])) break; if (_sp > XB_SPIN_CAP) { atomicAdd(&(bar)[XB_TMO], 1u); break; } } } } while (0)

struct XcdBarrier {
    unsigned* bar; unsigned x;
    volatile LAS unsigned* st;
};

__device__ __forceinline__ XcdBarrier xcd_barrier_post(unsigned* bar, volatile LAS unsigned* st) {
    XcdBarrier b; b.bar = bar; b.x = xb_xcc_id(); b.st = st;
    if (threadIdx.x == 0) (void)xb_add(&bar[XB_XCNT(b.x)], 1u);
    return b;
}
__device__ __forceinline__ void xcd_barrier_complete(unsigned* bar, unsigned x, unsigned& nloc, unsigned& nx) {
    const unsigned G = gridDim.x * gridDim.y * gridDim.z;
    unsigned sum, cnt, mine, sp = 0u;
    for (;;) {
        sum = 0u; cnt = 0u; mine = 0u;
#pragma unroll
        for (unsigned j = 0; j < 16; ++j) { const unsigned c = xb_ld(&bar[XB_XCNT(j)]); sum += c; cnt += (c > 0u) ? 1u : 0u; mine = (j == x) ? c : mine; }
        if (sum == G) break;
        __builtin_amdgcn_s_sleep(1);
        if ((++sp & 255u) == 0u) { if (xb_ld(&bar[XB_TMO])) break; if (sp > XB_SPIN_CAP) { atomicAdd(&bar[XB_TMO], 1u); break; } }
    }
    nloc = mine > 0u ? mine : 1u; nx = cnt > 0u ? cnt : 1u;
}

__device__ __forceinline__ void xcd_barrier(const XcdBarrier& b) {
    asm volatile("s_waitcnt vmcnt(0)" ::: "memory");
    __syncthreads();
    if (threadIdx.x == 0) {
        unsigned* bar = b.bar;
        __builtin_amdgcn_s_waitcnt(0);
        unsigned nloc = b.st[0], nx = b.st[1];
        if (nloc == 0u) { xcd_barrier_complete(bar, b.x, nloc, nx); b.st[0] = nloc; b.st[1] = nx; }
        const unsigned old = xb_add(&bar[XB_XSUB(b.x)], 1u);
        const unsigned gen = old / nloc;
        if (old + 1u == (gen + 1u) * nloc) {
            __builtin_amdgcn_fence(__ATOMIC_RELEASE, "agent");
            asm volatile("s_waitcnt vmcnt(0)" ::: "memory");
            const unsigned og = xb_add(&bar[XB_TOP], 1u);
            const unsigned tg = og / nx;
            if (og + 1u == (tg + 1u) * nx) xb_add(&bar[XB_TOPGEN], 1u);
            else XB_SPIN(xb_ld(&bar[XB_TOPGEN]) == tg, bar);
            __builtin_amdgcn_fence(__ATOMIC_ACQUIRE, "agent");
            xb_add(&bar[XB_XGEN(b.x)], 1u);
            asm volatile("s_waitcnt vmcnt(0)" ::: "memory");
        } else {
            XB_SPIN(xb_ld(&bar[XB_XGEN(b.x)]) == gen, bar);
            __builtin_amdgcn_fence(__ATOMIC_ACQUIRE, "agent");
            asm volatile("s_waitcnt vmcnt(0)" ::: "memory");
        }
    }
    __syncthreads();
}

struct Params { const float* in[27]; float* out; unsigned char* ws; int ph_lo, ph_hi; };
enum { I_X = 0, I_WIN, I_GMNG, I_GMNB, I_GMWS, I_GMBS, I_CONVW, I_ALOG, I_DTB, I_GDNNG, I_MLIB, I_MLFB, I_MLNG, I_WBR, I_WOUT, I_LN1G, I_LN1B,
       I_WR, I_RB, I_WG, I_WU, I_WD, I_SG, I_SU, I_SD, I_LN2G, I_LN2B };

using pg8::f32x4; using pg8::u32x4; using pg8::Unit; using pg8::HALF; using pg8::BM;

struct EpiGate8 {
    static constexpr bool PERM = true, AFTER_DRAIN = false; static constexpr int MID = 0;
    unsigned char* ZG; float sc;
    __device__ __forceinline__ void operator()(const f32x4 (&acc)[2][2][4][2], const Unit& u, int wr, int wc, int fr, int fq) const {
        const int row0 = u.pm * BM + wr * 64 + fr, col0 = u.pn * BM - ZC_GATE + wc * 32 + 8 * fq; const float k = sc * GSC;
#pragma unroll
        for (int ai = 0; ai < 2; ++ai)
#pragma unroll
            for (int m = 0; m < 4; ++m)
#pragma unroll
                for (int bj = 0; bj < 2; ++bj) { const f32x4 v0 = acc[ai][bj][m][0], v1 = acc[ai][bj][m][1];
                    *(v2u*)(ZG + (size_t)(row0 + ai * HALF + m * 16) * (4 * D) + col0 + bj * HALF) = (v2u){pk4_f8(v0[0], v0[1], v0[2], v0[3], k), pk4_f8(v1[0], v1[1], v1[2], v1[3], k)}; }
    }
};
struct EpiMergeH {
    static constexpr bool PERM = true, AFTER_DRAIN = false; static constexpr int MID = MERGE_FP8 ? BW / (2 * pg8::BK) : BW / pg8::BK;
    const bf16* Z; bf16* msum;
    __device__ __forceinline__ void mid(f32x4 (&acc)[2][2][4][2], const Unit& u, int j, int wr, int wc, int fr, int fq) const {
        int row0 = u.pm * BM + wr * 64 + fr; const int col0 = u.pn * BM + wc * 32 + 8 * fq; asm volatile("" : "+v"(row0));
#if GATE_FP8
        const unsigned char* zp = (const unsigned char*)Z + (size_t)(j - 1) * D + col0;
#else
        const bf16* zp = Z + ZC_GATE + (size_t)(j - 1) * D + col0;
#endif
#if GATE_FP8
        v2u ga[2][2][2], gb[2][2][2];
#else
        v4u ga[2][2][2], gb[2][2][2];
#endif
#if GATE_FP8
#define MH_LD1(buf, m, bj, ai_, m0_) do { const unsigned char* q = zp + (size_t)(row0 + ai_ * HALF + (m0_ + m) * 16) * (4 * D) + bj * HALF; ga[buf][m][bj] = *(const v2u*)q; gb[buf][m][bj] = *(const v2u*)(q + D); } while (0)
#define MH_UNPK(w, f) do { const auto _l0 = __builtin_amdgcn_cvt_pk_f32_fp8(w.x, false), _h0 = __builtin_amdgcn_cvt_pk_f32_fp8(w.x, true), _l1 = __builtin_amdgcn_cvt_pk_f32_fp8(w.y, false), _h1 = __builtin_amdgcn_cvt_pk_f32_fp8(w.y, true); \
        f[0] = _l0[0] * (1.f / GSC); f[1] = _l0[1] * (1.f / GSC); f[2] = _h0[0] * (1.f / GSC); f[3] = _h0[1] * (1.f / GSC); f[4] = _l1[0] * (1.f / GSC); f[5] = _l1[1] * (1.f / GSC); f[6] = _h1[0] * (1.f / GSC); f[7] = _h1[1] * (1.f / GSC); } while (0)
#else
#define MH_LD1(buf, m, bj, ai_, m0_) do { const bf16* q = zp + (size_t)(row0 + ai_ * HALF + (m0_ + m) * 16) * ZC + bj * HALF; ga[buf][m][bj] = *(const v4u*)q; gb[buf][m][bj] = *(const v4u*)(q + D); } while (0)
#define MH_UNPK(w, f) unpack8(w, f)
#endif
#define MH_LOAD(buf, am_) do { const int ai_ = (am_) >> 1, m0_ = ((am_) & 1) * 2; _Pragma("unroll") for (int m = 0; m < 2; ++m) _Pragma("unroll") for (int bj = 0; bj < 2; ++bj) { \
            MH_LD1(buf, m, bj, ai_, m0_); } } while (0)
#define MH_APPLY(buf, am_) do { const int ai_ = (am_) >> 1, m0_ = ((am_) & 1) * 2; _Pragma("unroll") for (int m = 0; m < 2; ++m) _Pragma("unroll") for (int bj = 0; bj < 2; ++bj) { float a[8], b[8]; MH_UNPK(ga[buf][m][bj], a); MH_UNPK(gb[buf][m][bj], b); \
            _Pragma("unroll") for (int i = 0; i < 8; ++i) { const float ea = __builtin_amdgcn_exp2f(fmaxf(a[i], -60.f) * -1.44269504f), eb = __builtin_amdgcn_exp2f(fmaxf(b[i], -60.f) * -1.44269504f); \
                acc[ai_][bj][m0_ + m][i >> 2][i & 3] *= (1.f + eb) * __builtin_amdgcn_rcpf(1.f + ea); } } } while (0)
        MH_LOAD(0, 0); MH_LOAD(1, 1); asm volatile("" ::: "memory");
        MH_APPLY(0, 0); asm volatile("" ::: "memory"); MH_LOAD(0, 2); asm volatile("" ::: "memory");
        MH_APPLY(1, 1); asm volatile("" ::: "memory"); MH_LOAD(1, 3); asm volatile("" ::: "memory");
        MH_APPLY(0, 2); asm volatile("" ::: "memory");
        MH_APPLY(1, 3); asm volatile("" ::: "memory");
#undef MH_LOAD
#undef MH_APPLY
#undef MH_LD1
    }
    __device__ __forceinline__ void operator()(const f32x4 (&acc)[2][2][4][2], const Unit& u, int wr, int wc, int fr, int fq) const {
        const int row0 = u.pm * BM + wr * 64 + fr, col0 = u.pn * BM + wc * 32 + 8 * fq;
#pragma unroll
#if GATE_FP8
        for (int ai = 0; ai < 2; ++ai) { v2u gg[4][2];
#pragma unroll
            for (int m = 0; m < 4; ++m)
#pragma unroll
                for (int bj = 0; bj < 2; ++bj) gg[m][bj] = *(const v2u*)((const unsigned char*)Z + (size_t)(row0 + ai * HALF + m * 16) * (4 * D) + 3 * D + col0 + bj * HALF);
#else
        for (int ai = 0; ai < 2; ++ai) { v4u gg[4][2];
#pragma unroll
            for (int m = 0; m < 4; ++m)
#pragma unroll
                for (int bj = 0; bj < 2; ++bj) gg[m][bj] = *(const v4u*)(Z + (size_t)(row0 + ai * HALF + m * 16) * ZC + ZC_GATE + 3 * D + col0 + bj * HALF);
#endif
#pragma unroll
            for (int m = 0; m < 4; ++m)
#pragma unroll
                for (int bj = 0; bj < 2; ++bj) { const size_t row = (size_t)(row0 + ai * HALF + m * 16); const int col = col0 + bj * HALF; float gl[8]; MH_UNPK(gg[m][bj], gl);
                    f32x4 v0 = acc[ai][bj][m][0], v1 = acc[ai][bj][m][1];
#pragma unroll
                    for (int j = 0; j < 4; ++j) { v0[j] *= sigmoidf_(gl[j]) * MGSC; v1[j] *= sigmoidf_(gl[4 + j]) * MGSC; }
                    unsigned w0 = 0, w1 = 0; w0 = __builtin_amdgcn_cvt_pk_fp8_f32(v0[0], v0[1], w0, false); w0 = __builtin_amdgcn_cvt_pk_fp8_f32(v0[2], v0[3], w0, true); w1 = __builtin_amdgcn_cvt_pk_fp8_f32(v1[0], v1[1], w1, false); w1 = __builtin_amdgcn_cvt_pk_fp8_f32(v1[2], v1[3], w1, true);
                    *(v2u*)((unsigned char*)msum + row * D + col) = (v2u){w0, w1}; }
            asm volatile("" ::: "memory"); }
    }
};
struct EpiResid {
    static constexpr bool PERM = true, AFTER_DRAIN = false; static constexpr int MID = 0;
    const void* X; bf16* Y; float sc; bool xbf;
    __device__ __forceinline__ void operator()(const f32x4 (&acc)[2][2][4][2], const Unit& u, int wr, int wc, int fr, int fq) const {
        const int row0 = u.pm * BM + wr * 64 + fr, col0 = u.pn * BM + wc * 32 + 8 * fq;
#pragma unroll
        for (int ai = 0; ai < 2; ++ai)
#pragma unroll
            for (int m = 0; m < 4; ++m) { const size_t off = (size_t)(row0 + ai * HALF + m * 16) * D + col0;
#pragma unroll
                for (int bj = 0; bj < 2; ++bj) { const f32x4 x0 = ld4(X, off + bj * HALF, xbf), x1 = ld4(X, off + bj * HALF + 4, xbf);
                    const f32x4 v0 = x0 * ALPHA + acc[ai][bj][m][0] * sc, v1 = x1 * ALPHA + acc[ai][bj][m][1] * sc;
                    u32x4 w; w.x = pk2(v0[0], v0[1]); w.y = pk2(v0[2], v0[3]); w.z = pk2(v1[0], v1[1]); w.w = pk2(v1[2], v1[3]); *(u32x4*)(Y + off + bj * HALF) = w; } }
    }
};
struct MoeTab {
    LAS int* t; LAS unsigned short* tok; LAS float* wt; LAS unsigned char* mte;
    __device__ __forceinline__ MoeTab(LAS unsigned char* lds) : t((LAS int*)(lds + TAB_OFF)), tok((LAS unsigned short*)(lds + TAB_OFF + 1024)), wt((LAS float*)(lds + TAB_OFF + 5120)), mte((LAS unsigned char*)(lds + TAB_OFF + 13312)) {}
};
__device__ __forceinline__ void moe_tables(const MoeTab& M, const unsigned* cnt  , int tid, int lane, int wave) {
    __syncthreads();
    if (wave == 0) { const int c = (int)cnt[64 * lane]; const int tiles = (c + 255) >> 8; const float incl = wave_scan_incl((float)tiles);
        M.t[80 + lane] = c; M.t[lane] = (int)incl - tiles; if (lane == 63) { M.t[64] = (int)incl; M.t[65] = (int)incl + T / 256; M.t[80 + 64] = T; } }
    __syncthreads();
    const int Mt = M.t[65];
    for (int mt = tid; mt < Mt; mt += 512) { int e = 0;
        for (int k = 1; k <= 64; ++k) e = (M.t[k] <= mt) ? k : e;
        M.mte[mt] = (unsigned char)e; }
    __syncthreads();
}
struct UpOrder {
    MoeTab M; int n;
    __device__ __forceinline__ bool next(int i, Unit& u) const { if (i >= n) return false; u.pm = M.t[168 + i]; u.pn = M.t[176 + i]; u.aux = i; return true; }
    __device__ __forceinline__ int row_token(int i, int r) const { return (int)M.tok[i * 256 + r]; }
    __device__ __forceinline__ void a_ready(const Unit&) const {}
    __device__ __forceinline__ void done(const Unit&) const {}
};
__device__ __forceinline__ int up_order_build(const MoeTab& M, const int* LIST, const float* WL, int wg, int G, int tid) {
    const int U = 4 * M.t[65];
    if (tid < 8) { const int L = tid * G + wg; if (L < U) { const int mt = L >> 2, q = L & 3, e = M.mte[mt]; M.t[168 + tid] = mt; M.t[176 + tid] = e * 4 + q; M.t[184 + tid] = e; M.t[192 + tid] = mt - M.t[e]; } }
    int n = 0;
#pragma unroll
    for (int i = 0; i < 8; ++i) n += (i * G + wg < U) ? 1 : 0;
    __syncthreads();
    for (int idx = tid; idx < n * 256; idx += 512) { const int i = idx >> 8, r = idx & 255, e = M.t[184 + i], li = M.t[192 + i] * 256 + r;
        int tk = 0; float w = 0.f;
        if (e < NE) { if (li < M.t[80 + e]) { tk = LIST[e * T + li]; w = WL[e * T + li]; } } else { tk = li; w = 1.f; }
        M.tok[idx] = (unsigned short)tk; M.wt[idx] = w; }
    __syncthreads();
    return n;
}
struct EpiGluSparse {
    static constexpr bool PERM = true, AFTER_DRAIN = false; static constexpr int MID = 0;
    LAS const float* wt; bf16* H;
    __device__ __forceinline__ void operator()(const f32x4 (&acc)[2][2][4][2], const Unit& u, int wr, int wc, int fr, int fq) const {
        const int q = u.pn & 3; const int rl0 = wr * 64 + fr, col0 = q * 128 + wc * 32 + 8 * fq;
#pragma unroll
        for (int ai = 0; ai < 2; ++ai)
#pragma unroll
            for (int m = 0; m < 4; ++m) { const int rl = rl0 + ai * HALF + m * 16; const float c = wt[u.aux * 256 + rl]; float h[8];
#pragma unroll
                for (int n = 0; n < 2; ++n)
#pragma unroll
                    for (int j = 0; j < 4; ++j) h[4 * n + j] = siluf_(acc[ai][0][m][n][j] * UPSC) * (acc[ai][1][m][n][j] * UPSC) * c;
#if MOE_DN_FP8
#pragma unroll
                for (int j = 0; j < 8; ++j) h[j] = __builtin_amdgcn_fmed3f(h[j] * HSC, -448.f, 448.f);
                unsigned w0 = 0, w1 = 0; w0 = __builtin_amdgcn_cvt_pk_fp8_f32(h[0], h[1], w0, false); w0 = __builtin_amdgcn_cvt_pk_fp8_f32(h[2], h[3], w0, true); w1 = __builtin_amdgcn_cvt_pk_fp8_f32(h[4], h[5], w1, false); w1 = __builtin_amdgcn_cvt_pk_fp8_f32(h[6], h[7], w1, true);
                *(v2u*)((unsigned char*)H + ((size_t)u.pm * 256 + rl) * ED + col0) = (v2u){w0, w1}; }
#else
                u32x4 w; w.x = pk2(h[0], h[1]); w.y = pk2(h[2], h[3]); w.z = pk2(h[4], h[5]); w.w = pk2(h[6], h[7]);
                *(u32x4*)(H + ((size_t)u.pm * 256 + rl) * ED + col0) = w; }
#endif
    }
};
struct DownOrder {
    MoeTab M; int G, c, U;
    __device__ __forceinline__ bool next(int i, Unit& u) const { const int L = i * G + c; if (L >= U) return false; const int mt = L >> 3, e = (int)M.mte[mt]; u.pm = mt; u.pn = e * 8 + (L & 7); const int left = M.t[80 + e] - 256 * (mt - M.t[e]); u.aux = left < 256 ? left : 256; return true; }
    __device__ __forceinline__ void a_ready(const Unit&) const {}
    __device__ __forceinline__ void done(const Unit&) const {}
};
struct EpiYexp {
    static constexpr bool PERM = true, AFTER_DRAIN = false; static constexpr int MID = 0;
    bf16* Y;
    __device__ __forceinline__ void operator()(const f32x4 (&acc)[2][2][4][2], const Unit& u, int wr, int wc, int fr, int fq) const {
        const int row0 = u.pm * BM + wr * 64 + fr, col0 = (u.pn & 7) * BM + wc * 32 + 8 * fq;
#pragma unroll
        for (int ai = 0; ai < 2; ++ai)
#pragma unroll
            for (int m = 0; m < 4; ++m) { bf16* rowp = Y + (size_t)(row0 + ai * HALF + m * 16) * D + col0;
                if (wr * 64 + fr + ai * HALF + m * 16 >= u.aux) continue;
#pragma unroll
                for (int bj = 0; bj < 2; ++bj) { const f32x4 v0 = acc[ai][bj][m][0] * DNSC, v1 = acc[ai][bj][m][1] * DNSC;
#if YEXP_FP8
                    *(v2u*)((unsigned char*)Y + (size_t)(row0 + ai * HALF + m * 16) * D + col0 + bj * HALF) = (v2u){pk4_f8(v0[0], v0[1], v0[2], v0[3], YSC), pk4_f8(v1[0], v1[1], v1[2], v1[3], YSC)}; } }
#else
                    u32x4 w; w.x = pk2(v0[0], v0[1]); w.y = pk2(v0[2], v0[3]); w.z = pk2(v1[0], v1[1]); w.w = pk2(v1[2], v1[3]); *(u32x4*)(rowp + bj * HALF) = w; } }
#endif
    }
};

struct TrItem { const float* src; bf16* dst; unsigned sld, dld; int f8; };
__device__ __forceinline__ void tr_load(const TrItem& t, int lane, v4f (&v)[8]) { const int r8 = lane >> 3, c4 = lane & 7;
#pragma unroll
    for (int i = 0; i < 8; ++i) v[i] = __builtin_nontemporal_load((const v4f*)(t.src + (size_t)(8 * i + r8) * t.sld + 4 * c4)); }
__device__ __forceinline__ void tr_store(const TrItem& t, const v4f (&v)[8], LAS float* scr, int lane, bool nostore = false) {
    { const int r8 = lane >> 3, c4 = lane & 7;
#pragma unroll
      for (int i = 0; i < 8; ++i) { LAS float* d = scr + (8 * i + r8) * 33 + 4 * c4; d[0] = v[i].x; d[1] = v[i].y; d[2] = v[i].z; d[3] = v[i].w; } }
    LDS_WAIT(); asm volatile("" ::: "memory");
    if (nostore) return;
    if (t.f8) {
        const int c = lane & 3;
#pragma unroll
        for (int j = 0; j < 2; ++j) { const int n = (lane >> 2) + 16 * j; const LAS float* s = scr + (16 * c) * 33 + n; unsigned w[4];
#pragma unroll
            for (int q = 0; q < 4; ++q) { unsigned x = 0; x = __builtin_amdgcn_cvt_pk_fp8_f32(s[(4 * q) * 33] * 64.f, s[(4 * q + 1) * 33] * 64.f, x, false); x = __builtin_amdgcn_cvt_pk_fp8_f32(s[(4 * q + 2) * 33] * 64.f, s[(4 * q + 3) * 33] * 64.f, x, true); w[q] = x; }
            __builtin_nontemporal_store((v4u){w[0], w[1], w[2], w[3]}, (v4u*)((unsigned char*)t.dst + (size_t)n * t.dld + 16 * c)); }
    } else {
        const int c = lane & 7;
#pragma unroll
        for (int j = 0; j < 4; ++j) { const int n = (lane >> 3) + 8 * j; const LAS float* s = scr + (8 * c) * 33 + n;
            v4u o; o.x = pk2(s[0 * 33], s[1 * 33]); o.y = pk2(s[2 * 33], s[3 * 33]); o.z = pk2(s[4 * 33], s[5 * 33]); o.w = pk2(s[6 * 33], s[7 * 33]);
            __builtin_nontemporal_store(o, (v4u*)(t.dst + (size_t)n * t.dld + 8 * c)); }
    }
    LDS_WAIT(); asm volatile("" ::: "memory");
}
template <int PART> __device__ __forceinline__ TrItem tr_decode(const Params& p, int l, int it) {
    unsigned char* ws = p.ws;
    constexpr int N_IN = (ZC / 32) * (D / 64), N_BR = 4 * (BW / 64) * (D / 32), N_OUT = (D / 64) * (D / 32), N_UP = NEX * 2 * (D / 64) * (ED / 32);
    int r = it; TrItem t; t.f8 = 0;
    if (PART == 0) {
        const float* w_in = p.in[I_WIN] + (size_t)l * D * INC; const float* w_br = p.in[I_WBR] + (size_t)l * 4 * BW * D; const float* w_out = p.in[I_WOUT] + (size_t)l * D * D;
        bf16* WIN = (bf16*)(ws + WS_WIN); bf16* WBR = (bf16*)(ws + WS_WBR); bf16* WOUT = (bf16*)(ws + WS_WOUT);
        if (r < N_IN) { const int kb = r / (ZC / 32), n0 = (r % (ZC / 32)) * 32, k0 = kb * 64; const int sc = n0 + (n0 >= ZC_GATE ? 16 : (n0 >= ZC_MLQ ? 8 : 0));
            t.src = w_in + (size_t)k0 * INC + sc; t.sld = INC; t.dst = (bf16*)((unsigned char*)WIN + (size_t)n0 * D + k0); t.dld = D; t.f8 = 1; return t; } r -= N_IN;
        if (r < N_BR) { const int g = r / 512, rr = r % 512, k0 = (rr / 64) * 64, n0 = (rr % 64) * 32;
            t.src = w_br + ((size_t)g * BW + k0) * D + n0; t.sld = D;
#if MERGE_FP8
            t.dst = (bf16*)((unsigned char*)WBR + (size_t)n0 * BRW + g * BW + k0); t.dld = BRW; t.f8 = 1; return t; }
#else
            t.dst = WBR + (size_t)n0 * BRW + g * BW + k0; t.dld = BRW; return t; }
#endif
        r -= N_BR;
        { const int k0 = (r / 64) * 64, n0 = (r % 64) * 32; t.src = w_out + (size_t)k0 * D + n0; t.sld = D; t.dst = (bf16*)((unsigned char*)WOUT + (size_t)n0 * D + k0); t.dld = D; t.f8 = 1; return t; }
    } else {
        const float* w_g = p.in[I_WG] + (size_t)l * NE * D * ED; const float* w_u = p.in[I_WU] + (size_t)l * NE * D * ED; const float* w_d = p.in[I_WD] + (size_t)l * NE * ED * D;
        const float* s_g = p.in[I_SG] + (size_t)l * D * ED; const float* s_u = p.in[I_SU] + (size_t)l * D * ED; const float* s_d = p.in[I_SD] + (size_t)l * ED * D;
        bf16* WUP = (bf16*)(ws + WS_WUP); bf16* WDN = (bf16*)(ws + WS_WDN);
        if (r < N_UP) { const int e = r / 1024, rr = r % 1024, mat = rr / 512, r2 = rr % 512, k0 = (r2 / 16) * 64, n0 = (r2 % 16) * 32;
            const float* sb = (e < NE) ? ((mat ? w_u : w_g) + (size_t)e * D * ED) : (mat ? s_u : s_g);
            const int drow = e * 1024 + (n0 / 128) * 256 + mat * 128 + (n0 % 128);
            t.src = sb + (size_t)k0 * ED + n0; t.sld = ED;
#if MOE_UP_FP8
            t.dst = (bf16*)((unsigned char*)WUP + (size_t)drow * D + k0); t.dld = D; t.f8 = 1; return t; }
#else
            t.dst = WUP + (size_t)drow * D + k0; t.dld = D; return t; }
#endif
        r -= N_UP;
        { const int e = r / 512, rr = r % 512, k0 = (rr / 64) * 64, n0 = (rr % 64) * 32;
            const float* sb = (e < NE) ? (w_d + (size_t)e * ED * D) : s_d;
            t.src = sb + (size_t)k0 * D + n0; t.sld = D;
#if MOE_DN_FP8
            t.dst = (bf16*)((unsigned char*)WDN + ((size_t)e * D + n0) * ED + k0); t.dld = ED; t.f8 = 1; return t; }
#else
            t.dst = WDN + ((size_t)e * D + n0) * ED + k0; t.dld = ED; return t; }
#endif
    }
}
template <int PART> __device__ __forceinline__ void phase_convert(const Params& p, int l, LAS unsigned char* lds, int gw, int NGW, int wave, int lane, bool nostore = false, int lo = 0, int hi = 1 << 30) {
    constexpr int N_IN = (ZC / 32) * (D / 64), N_BR = 4 * (BW / 64) * (D / 32), N_OUT = (D / 64) * (D / 32), N_UP = NEX * 2 * (D / 64) * (ED / 32), N_DN = NEX * (ED / 64) * (D / 32);
    constexpr int NITEMS = (PART == 0) ? (N_IN + N_BR + N_OUT) : (N_UP + N_DN);
    LAS float* scr = (LAS float*)(lds + wave * 16384);
    const int NIT = hi < NITEMS ? hi : NITEMS;
    if (lo + gw >= NIT) return;
    TrItem cur = tr_decode<PART>(p, l, lo + gw); v4f va[8], vb[8];
    tr_load(cur, lane, va);
    for (int it = lo + gw; it < NIT; it += 2 * NGW) {
        const int i1 = it + NGW, i2 = it + 2 * NGW; TrItem nx = cur;
        if (i1 < NIT) { nx = tr_decode<PART>(p, l, i1); } tr_load(nx, lane, vb);
        tr_store(cur, va, scr, lane, nostore);
        if (i1 >= NIT) break;
        cur = nx; if (i2 < NIT) { cur = tr_decode<PART>(p, l, i2); } tr_load(cur, lane, va);
        tr_store(nx, vb, scr, lane, nostore);
        if (i2 >= NIT) break;
    }
}
__device__ __forceinline__ void phase_xprep(const Params& p, int l, const void* xin, bool xbf, LAS unsigned char* lds, int gw, int NGW, int tid, int lane) {
    const float* w_in = p.in[I_WIN] + (size_t)l * D * INC;
    constexpr int XP = 2052; LAS float* xt = (LAS float*)lds; LAS float* part = (LAS float*)lds;
    const int wave = tid >> 6, n_l = lane & 15, kq = lane >> 4, wg = gw >> 3, G = NGW >> 3;
    const int colw = n_l < 8 ? 4608 + n_l : 6152 + (n_l - 8);
    float bw[64];
#pragma unroll
    for (int q = 0; q < 64; ++q) bw[q] = w_in[(size_t)(256 * wave + 16 * (q >> 2) + 4 * kq + (q & 3)) * INC + colw];
    unsigned char* XB = p.ws + WS_XB; float* SMALL = (float*)(p.ws + WS_SMALL);
    __syncthreads();
    for (int tg = wg; tg < T / 16; tg += G) {
        {   v4f va[8], vb[8]; const size_t m0 = (size_t)tg * 16 + 2 * wave;
#pragma unroll
            for (int j = 0; j < 8; ++j) { va[j] = ld4(xin, m0 * D + 4 * lane + 256 * j, xbf); vb[j] = ld4(xin, (m0 + 1) * D + 4 * lane + 256 * j, xbf); }
#pragma unroll
            for (int rr = 0; rr < 2; ++rr) { unsigned* xo = (unsigned*)(XB + (m0 + rr) * D) + lane;
#pragma unroll
                for (int j = 0; j < 8; ++j) { const v4f v = rr ? vb[j] : va[j]; unsigned w = 0; w = __builtin_amdgcn_cvt_pk_fp8_f32(v.x, v.y, w, false); w = __builtin_amdgcn_cvt_pk_fp8_f32(v.z, v.w, w, true); xo[64 * j] = w;
                    *(LAS v4f*)(xt + (2 * wave + rr) * XP + 4 * lane + 256 * j) = v; } } }
        __syncthreads();
        {   pg8::f32x4 acc[4];
#pragma unroll
            for (int i = 0; i < 4; ++i) acc[i] = (pg8::f32x4){0.f, 0.f, 0.f, 0.f};
            const LAS float* xa = xt + n_l * XP + 256 * wave + 4 * kq;
#pragma unroll
            for (int s2 = 0; s2 < 16; ++s2) { const v4f a4 = *(const LAS v4f*)(xa + 16 * s2);
                acc[0] = __builtin_amdgcn_mfma_f32_16x16x4f32(a4.x, bw[4 * s2 + 0], acc[0], 0, 0, 0); acc[1] = __builtin_amdgcn_mfma_f32_16x16x4f32(a4.y, bw[4 * s2 + 1], acc[1], 0, 0, 0);
                acc[2] = __builtin_amdgcn_mfma_f32_16x16x4f32(a4.z, bw[4 * s2 + 2], acc[2], 0, 0, 0); acc[3] = __builtin_amdgcn_mfma_f32_16x16x4f32(a4.w, bw[4 * s2 + 3], acc[3], 0, 0, 0); }
            const pg8::f32x4 tot = (acc[0] + acc[1]) + (acc[2] + acc[3]);
            __syncthreads();
#pragma unroll
            for (int j = 0; j < 4; ++j) part[(wave * 16 + 4 * kq + j) * 16 + n_l] = tot[j]; }
        __syncthreads();
        if (tid < 256) { float a = 0.f;
#pragma unroll
            for (int w = 0; w < 8; ++w) a += part[w * 256 + tid];
            SMALL[(size_t)tg * 256 + tid] = a; }
        __syncthreads();
    }
}


typedef short bf16x8_t __attribute__((ext_vector_type(8)));
__device__ __forceinline__ void ml_pre_item(const Params& p, int l, LAS unsigned char* lds, int item, int tid, int wave, int lane) {
    const int h = item & 3, n = item >> 2; const size_t t0 = (size_t)n * 64;
    const bf16* Z = (const bf16*)(p.ws + WS_Z); const float* SMALL = (const float*)(p.ws + WS_SMALL);
    bf16* MQ = (bf16*)(p.ws + WS_MQ) + (size_t)item * 4096; bf16* MS = (bf16*)(p.ws + WS_MS) + (size_t)item * 4096; bf16* MK = (bf16*)(p.ws + WS_MK) + (size_t)item * 4096;
    bf16* MV = (bf16*)(p.ws + WS_MV) + (size_t)item * 9216; float* MFL = (float*)(p.ws + WS_MFL);
    LAS float* qs = (LAS float*)lds;
    LAS float* ks = qs + 64 * 65;
    LAS float* bs = ks + 64 * 65;
    LAS unsigned short* vs = (LAS unsigned short*)(bs + 128);
    { const int tk = tid >> 3, c8 = tid & 7; float f[8];
      unpack8(*(const v4u*)(Z + (t0 + tk) * ZC + ZC_MLQ + h * 64 + 8 * c8), f);
#pragma unroll
      for (int i = 0; i < 8; ++i) qs[tk * 65 + 8 * c8 + i] = f[i];
      unpack8(*(const v4u*)(Z + (t0 + tk) * ZC + ZC_MLK + h * 64 + 8 * c8), f);
#pragma unroll
      for (int i = 0; i < 8; ++i) ks[tk * 65 + 8 * c8 + i] = f[i]; }
#pragma unroll
    for (int r = 0; r < 2; ++r) { const int idx = tid + 512 * r, tk = idx >> 4, c8 = idx & 15;
        *(LAS v4u*)(vs + tk * 136 + 8 * c8) = *(const v4u*)(Z + (t0 + tk) * ZC + ZC_MLV + h * 128 + 8 * c8); }
    if (wave == 0) { const float fp = SMALL[(t0 + lane) * 16 + 12 + h] + p.in[I_MLFB][l * 4 + h]; const float lf = -softplusf_(-fp);
        bs[lane] = wave_scan_incl(lf); bs[64 + lane] = SMALL[(t0 + lane) * 16 + 8 + h] + p.in[I_MLIB][l * 4 + h]; }
    __syncthreads();
    const float blast = bs[63];
    { const int i = tid >> 3, jb = tid & 7; const float bi = bs[i];
      { const float e = __expf(bi) * 0.125f; float o[8];
#pragma unroll
        for (int x = 0; x < 8; ++x) o[x] = qs[i * 65 + 8 * jb + x] * e;
        v4u w; w.x = pk2(o[0], o[1]); w.y = pk2(o[2], o[3]); w.z = pk2(o[4], o[5]); w.w = pk2(o[6], o[7]); *(v4u*)(MQ + i * 64 + 8 * jb) = w; }
      {
          const int ti = wave >> 1, c16 = lane & 15, g4 = lane >> 4, i2 = 16 * ti + c16; const float bi2 = bs[i2];
#define ML_F8(dst, base) do { const LAS float* _b = (base); const v4u _w = (v4u){pg8::cvt_pk_bf16(_b[0], _b[1]), pg8::cvt_pk_bf16(_b[2], _b[3]), pg8::cvt_pk_bf16(_b[4], _b[5]), pg8::cvt_pk_bf16(_b[6], _b[7])}; dst = __builtin_bit_cast(bf16x8_t, _w); } while (0)
          bf16x8_t bq[2];
#pragma unroll
          for (int s2 = 0; s2 < 2; ++s2) ML_F8(bq[s2], qs + i2 * 65 + 32 * s2 + 8 * g4);
#pragma unroll
          for (int jj = 0; jj < 2; ++jj) { const int tj = 2 * (wave & 1) + jj; v2u sw = (v2u){0u, 0u};
              if (tj <= ti) { pg8::f32x4 d = {0.f, 0.f, 0.f, 0.f};
#pragma unroll
                  for (int s2 = 0; s2 < 2; ++s2) { bf16x8_t a; ML_F8(a, ks + (16 * tj + c16) * 65 + 32 * s2 + 8 * g4); d = __builtin_amdgcn_mfma_f32_16x16x32_bf16(a, bq[s2], d, 0, 0, 0); }
                  float v4[4];
#pragma unroll
                  for (int r = 0; r < 4; ++r) { const int j = 16 * tj + 4 * g4 + r; v4[r] = (j <= i2) ? __expf(bi2 - bs[j] + bs[64 + j]) * d[r] * 0.125f : 0.f; }
                  sw = (v2u){pk2(v4[0], v4[1]), pk2(v4[2], v4[3])}; }
              *(v2u*)(MS + i2 * 64 + 16 * tj + 4 * g4) = sw; }
#undef ML_F8
      }
      { float o[8];
#pragma unroll
        for (int x = 0; x < 8; ++x) { const int j = 8 * jb + x; o[x] = ks[j * 65 + i] * __expf(blast - bs[j] + bs[64 + j]); }
        v4u w; w.x = pk2(o[0], o[1]); w.y = pk2(o[2], o[3]); w.z = pk2(o[4], o[5]); w.w = pk2(o[6], o[7]); *(v4u*)(MK + i * 64 + 8 * jb) = w; }
    }
    { const int c = tid >> 2, jq = tid & 3; unsigned w[8];
#pragma unroll
      for (int x = 0; x < 8; ++x) w[x] = (unsigned)vs[(16 * jq + 2 * x) * 136 + c] | ((unsigned)vs[(16 * jq + 2 * x + 1) * 136 + c] << 16);
      *(v4u*)(MV + c * 64 + 16 * jq) = (v4u){w[0], w[1], w[2], w[3]}; *(v4u*)(MV + c * 64 + 16 * jq + 8) = (v4u){w[4], w[5], w[6], w[7]};
      if (tid < 64) { const int c2 = 128 + (tid >> 2); const unsigned one = (c2 == 128) ? 0x3F803F80u : 0u;
          *(v4u*)(MV + c2 * 64 + 16 * jq) = (v4u){one, one, one, one}; *(v4u*)(MV + c2 * 64 + 16 * jq + 8) = (v4u){one, one, one, one}; } }
    if (tid == 0) MFL[item] = __expf(blast);
    __syncthreads();
}
struct MlFrags { bf16x8_t q[2], s[2], kt[2], vt[2]; float fl; };
__device__ __forceinline__ void ml_load(MlFrags& F, const Params& p, int item, int offA, int offV) {
    const bf16* MQ = (const bf16*)(p.ws + WS_MQ) + (size_t)item * 4096; const bf16* MS = (const bf16*)(p.ws + WS_MS) + (size_t)item * 4096; const bf16* MK = (const bf16*)(p.ws + WS_MK) + (size_t)item * 4096;
    const bf16* MV = (const bf16*)(p.ws + WS_MV) + (size_t)item * 9216;
#pragma unroll
    for (int ks = 0; ks < 2; ++ks) { F.q[ks] = *(const bf16x8_t*)(MQ + offA + 32 * ks); F.s[ks] = *(const bf16x8_t*)(MS + offA + 32 * ks); F.kt[ks] = *(const bf16x8_t*)(MK + offA + 32 * ks); F.vt[ks] = *(const bf16x8_t*)(MV + offV + 32 * ks); }
    F.fl = ((const float*)(p.ws + WS_MFL))[item];
}
__device__ __forceinline__ void ml_seq(const Params& p, LAS unsigned char* lds, int wgi, int wave, int lane) {
    const int u = wgi * 2 + (wave >> 2), wi = wave & 3, h = u / 9, sl = u % 9, g = lane >> 4, c = lane & 15;
    LAS unsigned short* CT = (LAS unsigned short*)(lds + (wave >> 2) * 4096);
    float* HO = (float*)(p.ws + WS_HO); float* HDEN = (float*)(p.ws + WS_HDEN);
    const int offA = (16 * wi + c) * 64 + 8 * g, offV = (16 * sl + c) * 64 + 8 * g;
    *(LAS v2u*)(CT + c * 64 + 16 * wi + 4 * g) = (v2u){0u, 0u};
    pg8::f32x4 Cacc = {0.f, 0.f, 0.f, 0.f};
    __syncthreads();
    MlFrags F0, F1;
    ml_load(F0, p, h, offA, offV);
#define ML_STEP(F, n_) do { const int cur = (n_) & 1; \
        const bf16x8_t c0 = *(const LAS bf16x8_t*)(CT + cur * 1024 + c * 64 + 8 * g), c1 = *(const LAS bf16x8_t*)(CT + cur * 1024 + c * 64 + 32 + 8 * g); \
        pg8::f32x4 num = {0.f, 0.f, 0.f, 0.f}; \
        num = __builtin_amdgcn_mfma_f32_16x16x32_bf16(F.q[0], c0, num, 0, 0, 0); num = __builtin_amdgcn_mfma_f32_16x16x32_bf16(F.q[1], c1, num, 0, 0, 0); \
        num = __builtin_amdgcn_mfma_f32_16x16x32_bf16(F.s[0], F.vt[0], num, 0, 0, 0); num = __builtin_amdgcn_mfma_f32_16x16x32_bf16(F.s[1], F.vt[1], num, 0, 0, 0); \
        Cacc = Cacc * F.fl; \
        Cacc = __builtin_amdgcn_mfma_f32_16x16x32_bf16(F.kt[0], F.vt[0], Cacc, 0, 0, 0); Cacc = __builtin_amdgcn_mfma_f32_16x16x32_bf16(F.kt[1], F.vt[1], Cacc, 0, 0, 0); \
        { v2u w; w.x = pk2(Cacc[0], Cacc[1]); w.y = pk2(Cacc[2], Cacc[3]); *(LAS v2u*)(CT + (cur ^ 1) * 1024 + c * 64 + 16 * wi + 4 * g) = w; } \
        { const size_t tb = (size_t)(n_) * 64 + 16 * wi + 4 * g; \
          if (sl < 8) { _Pragma("unroll") for (int r = 0; r < 4; ++r) HO[(tb + r) * BW + h * 128 + 16 * sl + c] = num[r]; } \
          else if (c == 0) { _Pragma("unroll") for (int r = 0; r < 4; ++r) HDEN[(tb + r) * 4 + h] = num[r]; } } \
        LDS_BAR(); } while (0)
    for (int n = 0; n < T / 64; n += 2) {
        ml_load(F1, p, (n + 1) * 4 + h, offA, offV);
        ML_STEP(F0, n);
        ml_load(F0, p, ((n + 2 < T / 64) ? n + 2 : n) * 4 + h, offA, offV);
        ML_STEP(F1, n + 1);
    }
#undef ML_STEP
}


constexpr int QP = 132;
__device__ __forceinline__ void gdn_pre_item(const Params& p, int l, LAS unsigned char* lds, int item, int tid, int wave, int lane) {
    const int h = item & 3, n = item >> 2; const size_t t0 = (size_t)n * 64;
    const bf16* Z = (const bf16*)(p.ws + WS_Z); const float* SMALL = (const float*)(p.ws + WS_SMALL);
    float* GU = (float*)(p.ws + WS_GU) + (size_t)item * 8192; bf16* GNW = (bf16*)(p.ws + WS_GNW) + (size_t)item * 8192; bf16* GQG = (bf16*)(p.ws + WS_GQG) + (size_t)item * 8192;
    bf16* GAT = (bf16*)(p.ws + WS_GAT) + (size_t)item * 4096; bf16* GKT = (bf16*)(p.ws + WS_GKT) + (size_t)item * 8192; float* GDL = (float*)(p.ws + WS_GDL);
    const float* cw = p.in[I_CONVW] + (size_t)l * 4 * 1536;
    LAS float* qs = (LAS float*)lds; LAS float* ks = qs + 64 * QP; LAS float* vs = ks + 64 * QP; LAS float* Ls = vs + 64 * QP;   LAS float* gcs = Ls + 64 * 68; LAS float* bts = gcs + 64; LAS float* btg = bts + 64;
    LAS unsigned short* zq = (LAS unsigned short*)(lds + 131584); LAS unsigned short* zk = (LAS unsigned short*)Ls; LAS unsigned short* zv = (LAS unsigned short*)vs; LAS float* cwl = btg + 64;
    float gate_b = 0.f, gate_a = 0.f; if (wave == 0) { gate_b = SMALL[(t0 + lane) * 16 + h]; gate_a = SMALL[(t0 + lane) * 16 + 4 + h]; }
    {   v4u zr[7]; v4f wr4 = (v4f){0.f, 0.f, 0.f, 0.f};
#pragma unroll
        for (int q = 0; q < 7; ++q) { const int idx = tid + 512 * q; zr[q] = (v4u){0u, 0u, 0u, 0u};
            if (idx < 3216) { const int seg = idx / 1072, rem = idx % 1072, r = rem >> 4, c16 = rem & 15; const long tt = (long)t0 - 3 + r;
                if (tt >= 0) zr[q] = *(const v4u*)(Z + (size_t)tt * ZC + ZC_GDN + seg * 512 + h * 128 + 8 * c16); } }
        if (tid < 384) { const int j = tid / 96, rest = tid % 96, i = rest >> 5, c4 = rest & 31; wr4 = *(const v4f*)(cw + j * 1536 + i * 512 + h * 128 + 4 * c4); }
#pragma unroll
        for (int q = 0; q < 7; ++q) { const int idx = tid + 512 * q;
            if (idx < 3216) { const int seg = idx / 1072, rem = idx % 1072; LAS unsigned short* zb = seg == 0 ? zq : (seg == 1 ? zk : zv); *(LAS v4u*)(zb + 8 * rem) = zr[q]; } }
        if (tid < 384) *(LAS v4f*)(cwl + 4 * tid) = wr4;
    }
    __syncthreads();
    { const int tk = tid >> 3, part = tid & 7; float av[16];
#pragma unroll 1
      for (int i = 0; i < 3; ++i) { float a[16]; const LAS unsigned short* zb = i == 0 ? zq : (i == 1 ? zk : zv);
#pragma unroll
        for (int x = 0; x < 16; ++x) a[x] = 0.f;
#pragma unroll
        for (int j = 0; j < 4; ++j) { const LAS unsigned short* src = zb + (tk + j) * 128 + 16 * part; float x0[8], x1[8]; unpack8(*(const LAS v4u*)src, x0); unpack8(*(const LAS v4u*)(src + 8), x1);
            const LAS float* wp = cwl + (j * 3 + i) * 128 + 16 * part;
#pragma unroll
            for (int x4 = 0; x4 < 2; ++x4) { const v4f w0 = *(const LAS v4f*)(wp + 4 * x4), w1 = *(const LAS v4f*)(wp + 8 + 4 * x4);
                a[4 * x4] += w0.x * x0[4 * x4]; a[4 * x4 + 1] += w0.y * x0[4 * x4 + 1]; a[4 * x4 + 2] += w0.z * x0[4 * x4 + 2]; a[4 * x4 + 3] += w0.w * x0[4 * x4 + 3];
                a[8 + 4 * x4] += w1.x * x1[4 * x4]; a[8 + 4 * x4 + 1] += w1.y * x1[4 * x4 + 1]; a[8 + 4 * x4 + 2] += w1.z * x1[4 * x4 + 2]; a[8 + 4 * x4 + 3] += w1.w * x1[4 * x4 + 3]; } }
        float ss = 0.f;
#pragma unroll
        for (int x = 0; x < 16; ++x) { a[x] = siluf_(a[x]); ss += a[x] * a[x]; }
        if (i < 2) { ss = sum8(ss); const float r = rsqrtf(ss + 1e-6f) * (i == 0 ? 0.08838834764831845f : 1.f);
#pragma unroll
            for (int x = 0; x < 16; ++x) a[x] *= r;
            LAS float* dst = (i == 0 ? qs : ks) + tk * QP + 16 * part;
#pragma unroll
            for (int x4 = 0; x4 < 4; ++x4) *(LAS v4f*)(dst + 4 * x4) = (v4f){a[4 * x4], a[4 * x4 + 1], a[4 * x4 + 2], a[4 * x4 + 3]}; }
        else {
#pragma unroll
            for (int x = 0; x < 16; ++x) av[x] = a[x]; } }
      __syncthreads();
      { LAS float* dst = vs + tk * QP + 16 * part;
#pragma unroll
        for (int x4 = 0; x4 < 4; ++x4) *(LAS v4f*)(dst + 4 * x4) = (v4f){av[4 * x4], av[4 * x4 + 1], av[4 * x4 + 2], av[4 * x4 + 3]}; } }
    if (wave == 0) { const float bb = gate_b, aa = gate_a;
        const float g = -__expf(p.in[I_ALOG][l * 4 + h]) * softplusf_(aa + p.in[I_DTB][l * 4 + h]);
        const float gc = wave_scan_incl(g), bt = sigmoidf_(bb); gcs[lane] = gc; bts[lane] = bt; btg[lane] = bt * __expf(gc); }
    __syncthreads();
    { const int ti = wave >> 1, c16 = lane & 15, g4 = lane >> 4, i = 16 * ti + c16; const float gi = gcs[i], bi = bts[i];
#define GDN_F8(dst, base) do { const v4f _a = *(const LAS v4f*)(base), _b = *(const LAS v4f*)((base) + 4); const v4u _w = (v4u){pg8::cvt_pk_bf16(_a.x, _a.y), pg8::cvt_pk_bf16(_a.z, _a.w), pg8::cvt_pk_bf16(_b.x, _b.y), pg8::cvt_pk_bf16(_b.z, _b.w)}; dst = __builtin_bit_cast(bf16x8_t, _w); } while (0)
      bf16x8_t bk[4], bq[4];
#pragma unroll
      for (int s4 = 0; s4 < 4; ++s4) { GDN_F8(bk[s4], ks + i * QP + 32 * s4 + 8 * g4); GDN_F8(bq[s4], qs + i * QP + 32 * s4 + 8 * g4); }
#pragma unroll
      for (int jj = 0; jj < 2; ++jj) { const int tj = 2 * (wave & 1) + jj; v4f lv = (v4f){0.f, 0.f, 0.f, 0.f}; v2u aw = (v2u){0u, 0u};
          if (tj <= ti) { pg8::f32x4 dk = {0.f, 0.f, 0.f, 0.f}, dq = {0.f, 0.f, 0.f, 0.f};
#pragma unroll
              for (int s4 = 0; s4 < 4; ++s4) { bf16x8_t a; GDN_F8(a, ks + (16 * tj + c16) * QP + 32 * s4 + 8 * g4);
                  dk = __builtin_amdgcn_mfma_f32_16x16x32_bf16(a, bk[s4], dk, 0, 0, 0); dq = __builtin_amdgcn_mfma_f32_16x16x32_bf16(a, bq[s4], dq, 0, 0, 0); }
              float l4[4], a4[4];
#pragma unroll
              for (int r = 0; r < 4; ++r) { const int j = 16 * tj + 4 * g4 + r; const float dc = __expf(gi - gcs[j]); l4[r] = (j < i) ? bi * dk[r] * dc : 0.f; a4[r] = (j <= i) ? dq[r] * dc : 0.f; }
              lv = (v4f){l4[0], l4[1], l4[2], l4[3]}; aw = (v2u){pk2(a4[0], a4[1]), pk2(a4[2], a4[3])}; }
          *(LAS v4f*)(Ls + i * 68 + 16 * tj + 4 * g4) = lv; *(v2u*)(GAT + i * 64 + 16 * tj + 4 * g4) = aw; }
#undef GDN_F8
    }
    __syncthreads();
    if (tid < 256) {
        const int c = tid; int vz; asm volatile("v_mov_b32 %0, 0" : "=v"(vz));
        const LAS float* rp = (c < 128) ? (vs + c) : (ks + (c - 128)); const LAS float* mp = ((c < 128) ? bts : btg) + vz;
#define GDN_RHS(i) (rp[(i) * QP] * mp[(i)])
#define GDN_L4(i, j4) (*(const LAS v4f*)(Ls + (i) * 68 + 4 * (j4) + vz))
        float x0 = GDN_RHS(0); __builtin_amdgcn_sched_barrier(0);
        float x1 = GDN_RHS(1); { const v4f l0 = GDN_L4(1, 0); __builtin_amdgcn_sched_barrier(0); x1 -= l0.x * x0; } __builtin_amdgcn_sched_barrier(0);
        float x2 = GDN_RHS(2); { const v4f l0 = GDN_L4(2, 0); __builtin_amdgcn_sched_barrier(0); x2 -= l0.x * x0; x2 -= l0.y * x1; } __builtin_amdgcn_sched_barrier(0);
        float x3 = GDN_RHS(3); { const v4f l0 = GDN_L4(3, 0); __builtin_amdgcn_sched_barrier(0); x3 -= l0.x * x0; x3 -= l0.y * x1; x3 -= l0.z * x2; } __builtin_amdgcn_sched_barrier(0);
        float x4 = GDN_RHS(4); { const v4f l0 = GDN_L4(4, 0); __builtin_amdgcn_sched_barrier(0); x4 -= l0.x * x0; x4 -= l0.y * x1; x4 -= l0.z * x2; x4 -= l0.w * x3; } __builtin_amdgcn_sched_barrier(0);
        float x5 = GDN_RHS(5); { const v4f l0 = GDN_L4(5, 0); const v4f l1 = GDN_L4(5, 1); __builtin_amdgcn_sched_barrier(0); x5 -= l0.x * x0; x5 -= l0.y * x1; x5 -= l0.z * x2; x5 -= l0.w * x3; x5 -= l1.x * x4; } __builtin_amdgcn_sched_barrier(0);
        float x6 = GDN_RHS(6); { const v4f l0 = GDN_L4(6, 0); const v4f l1 = GDN_L4(6, 1); __builtin_amdgcn_sched_barrier(0); x6 -= l0.x * x0; x6 -= l0.y * x1; x6 -= l0.z * x2; x6 -= l0.w * x3; x6 -= l1.x * x4; x6 -= l1.y * x5; } __builtin_amdgcn_sched_barrier(0);
        float x7 = GDN_RHS(7); { const v4f l0 = GDN_L4(7, 0); const v4f l1 = GDN_L4(7, 1); __builtin_amdgcn_sched_barrier(0); x7 -= l0.x * x0; x7 -= l0.y * x1; x7 -= l0.z * x2; x7 -= l0.w * x3; x7 -= l1.x * x4; x7 -= l1.y * x5; x7 -= l1.z * x6; } __builtin_amdgcn_sched_barrier(0);
        float x8 = GDN_RHS(8); { const v4f l0 = GDN_L4(8, 0); const v4f l1 = GDN_L4(8, 1); __builtin_amdgcn_sched_barrier(0); x8 -= l0.x * x0; x8 -= l0.y * x1; x8 -= l0.z * x2; x8 -= l0.w * x3; x8 -= l1.x * x4; x8 -= l1.y * x5; x8 -= l1.z * x6; x8 -= l1.w * x7; } __builtin_amdgcn_sched_barrier(0);
        float x9 = GDN_RHS(9); { const v4f l0 = GDN_L4(9, 0); const v4f l1 = GDN_L4(9, 1); const v4f l2 = GDN_L4(9, 2); __builtin_amdgcn_sched_barrier(0); x9 -= l0.x * x0; x9 -= l0.y * x1; x9 -= l0.z * x2; x9 -= l0.w * x3; x9 -= l1.x * x4; x9 -= l1.y * x5; x9 -= l1.z * x6; x9 -= l1.w * x7; x9 -= l2.x * x8; } __builtin_amdgcn_sched_barrier(0);
        float x10 = GDN_RHS(10); { const v4f l0 = GDN_L4(10, 0); const v4f l1 = GDN_L4(10, 1); const v4f l2 = GDN_L4(10, 2); __builtin_amdgcn_sched_barrier(0); x10 -= l0.x * x0; x10 -= l0.y * x1; x10 -= l0.z * x2; x10 -= l0.w * x3; x10 -= l1.x * x4; x10 -= l1.y * x5; x10 -= l1.z * x6; x10 -= l1.w * x7; x10 -= l2.x * x8; x10 -= l2.y * x9; } __builtin_amdgcn_sched_barrier(0);
        float x11 = GDN_RHS(11); { const v4f l0 = GDN_L4(11, 0); const v4f l1 = GDN_L4(11, 1); const v4f l2 = GDN_L4(11, 2); __builtin_amdgcn_sched_barrier(0); x11 -= l0.x * x0; x11 -= l0.y * x1; x11 -= l0.z * x2; x11 -= l0.w * x3; x11 -= l1.x * x4; x11 -= l1.y * x5; x11 -= l1.z * x6; x11 -= l1.w * x7; x11 -= l2.x * x8; x11 -= l2.y * x9; x11 -= l2.z * x10; } __builtin_amdgcn_sched_barrier(0);
        float x12 = GDN_RHS(12); { const v4f l0 = GDN_L4(12, 0); const v4f l1 = GDN_L4(12, 1); const v4f l2 = GDN_L4(12, 2); __builtin_amdgcn_sched_barrier(0); x12 -= l0.x * x0; x12 -= l0.y * x1; x12 -= l0.z * x2; x12 -= l0.w * x3; x12 -= l1.x * x4; x12 -= l1.y * x5; x12 -= l1.z * x6; x12 -= l1.w * x7; x12 -= l2.x * x8; x12 -= l2.y * x9; x12 -= l2.z * x10; x12 -= l2.w * x11; } __builtin_amdgcn_sched_barrier(0);
        float x13 = GDN_RHS(13); { const v4f l0 = GDN_L4(13, 0); const v4f l1 = GDN_L4(13, 1); const v4f l2 = GDN_L4(13, 2); const v4f l3 = GDN_L4(13, 3); __builtin_amdgcn_sched_barrier(0); x13 -= l0.x * x0; x13 -= l0.y * x1; x13 -= l0.z * x2; x13 -= l0.w * x3; x13 -= l1.x * x4; x13 -= l1.y * x5; x13 -= l1.z * x6; x13 -= l1.w * x7; x13 -= l2.x * x8; x13 -= l2.y * x9; x13 -= l2.z * x10; x13 -= l2.w * x11; x13 -= l3.x * x12; } __builtin_amdgcn_sched_barrier(0);
        float x14 = GDN_RHS(14); { const v4f l0 = GDN_L4(14, 0); const v4f l1 = GDN_L4(14, 1); const v4f l2 = GDN_L4(14, 2); const v4f l3 = GDN_L4(14, 3); __builtin_amdgcn_sched_barrier(0); x14 -= l0.x * x0; x14 -= l0.y * x1; x14 -= l0.z * x2; x14 -= l0.w * x3; x14 -= l1.x * x4; x14 -= l1.y * x5; x14 -= l1.z * x6; x14 -= l1.w * x7; x14 -= l2.x * x8; x14 -= l2.y * x9; x14 -= l2.z * x10; x14 -= l2.w * x11; x14 -= l3.x * x12; x14 -= l3.y * x13; } __builtin_amdgcn_sched_barrier(0);
        float x15 = GDN_RHS(15); { const v4f l0 = GDN_L4(15, 0); const v4f l1 = GDN_L4(15, 1); const v4f l2 = GDN_L4(15, 2); const v4f l3 = GDN_L4(15, 3); __builtin_amdgcn_sched_barrier(0); x15 -= l0.x * x0; x15 -= l0.y * x1; x15 -= l0.z * x2; x15 -= l0.w * x3; x15 -= l1.x * x4; x15 -= l1.y * x5; x15 -= l1.z * x6; x15 -= l1.w * x7; x15 -= l2.x * x8; x15 -= l2.y * x9; x15 -= l2.z * x10; x15 -= l2.w * x11; x15 -= l3.x * x12; x15 -= l3.y * x13; x15 -= l3.z * x14; } __builtin_amdgcn_sched_barrier(0);
        float x16 = GDN_RHS(16); { const v4f l0 = GDN_L4(16, 0); const v4f l1 = GDN_L4(16, 1); const v4f l2 = GDN_L4(16, 2); const v4f l3 = GDN_L4(16, 3); __builtin_amdgcn_sched_barrier(0); x16 -= l0.x * x0; x16 -= l0.y * x1; x16 -= l0.z * x2; x16 -= l0.w * x3; x16 -= l1.x * x4; x16 -= l1.y * x5; x16 -= l1.z * x6; x16 -= l1.w * x7; x16 -= l2.x * x8; x16 -= l2.y * x9; x16 -= l2.z * x10; x16 -= l2.w * x11; x16 -= l3.x * x12; x16 -= l3.y * x13; x16 -= l3.z * x14; x16 -= l3.w * x15; } __builtin_amdgcn_sched_barrier(0);
        float x17 = GDN_RHS(17); { const v4f l0 = GDN_L4(17, 0); const v4f l1 = GDN_L4(17, 1); const v4f l2 = GDN_L4(17, 2); const v4f l3 = GDN_L4(17, 3); const v4f l4 = GDN_L4(17, 4); __builtin_amdgcn_sched_barrier(0); x17 -= l0.x * x0; x17 -= l0.y * x1; x17 -= l0.z * x2; x17 -= l0.w * x3; x17 -= l1.x * x4; x17 -= l1.y * x5; x17 -= l1.z * x6; x17 -= l1.w * x7; x17 -= l2.x * x8; x17 -= l2.y * x9; x17 -= l2.z * x10; x17 -= l2.w * x11; x17 -= l3.x * x12; x17 -= l3.y * x13; x17 -= l3.z * x14; x17 -= l3.w * x15; x17 -= l4.x * x16; } __builtin_amdgcn_sched_barrier(0);
        float x18 = GDN_RHS(18); { const v4f l0 = GDN_L4(18, 0); const v4f l1 = GDN_L4(18, 1); const v4f l2 = GDN_L4(18, 2); const v4f l3 = GDN_L4(18, 3); const v4f l4 = GDN_L4(18, 4); __builtin_amdgcn_sched_barrier(0); x18 -= l0.x * x0; x18 -= l0.y * x1; x18 -= l0.z * x2; x18 -= l0.w * x3; x18 -= l1.x * x4; x18 -= l1.y * x5; x18 -= l1.z * x6; x18 -= l1.w * x7; x18 -= l2.x * x8; x18 -= l2.y * x9; x18 -= l2.z * x10; x18 -= l2.w * x11; x18 -= l3.x * x12; x18 -= l3.y * x13; x18 -= l3.z * x14; x18 -= l3.w * x15; x18 -= l4.x * x16; x18 -= l4.y * x17; } __builtin_amdgcn_sched_barrier(0);
        float x19 = GDN_RHS(19); { const v4f l0 = GDN_L4(19, 0); const v4f l1 = GDN_L4(19, 1); const v4f l2 = GDN_L4(19, 2); const v4f l3 = GDN_L4(19, 3); const v4f l4 = GDN_L4(19, 4); __builtin_amdgcn_sched_barrier(0); x19 -= l0.x * x0; x19 -= l0.y * x1; x19 -= l0.z * x2; x19 -= l0.w * x3; x19 -= l1.x * x4; x19 -= l1.y * x5; x19 -= l1.z * x6; x19 -= l1.w * x7; x19 -= l2.x * x8; x19 -= l2.y * x9; x19 -= l2.z * x10; x19 -= l2.w * x11; x19 -= l3.x * x12; x19 -= l3.y * x13; x19 -= l3.z * x14; x19 -= l3.w * x15; x19 -= l4.x * x16; x19 -= l4.y * x17; x19 -= l4.z * x18; } __builtin_amdgcn_sched_barrier(0);
        float x20 = GDN_RHS(20); { const v4f l0 = GDN_L4(20, 0); const v4f l1 = GDN_L4(20, 1); const v4f l2 = GDN_L4(20, 2); const v4f l3 = GDN_L4(20, 3); const v4f l4 = GDN_L4(20, 4); __builtin_amdgcn_sched_barrier(0); x20 -= l0.x * x0; x20 -= l0.y * x1; x20 -= l0.z * x2; x20 -= l0.w * x3; x20 -= l1.x * x4; x20 -= l1.y * x5; x20 -= l1.z * x6; x20 -= l1.w * x7; x20 -= l2.x * x8; x20 -= l2.y * x9; x20 -= l2.z * x10; x20 -= l2.w * x11; x20 -= l3.x * x12; x20 -= l3.y * x13; x20 -= l3.z * x14; x20 -= l3.w * x15; x20 -= l4.x * x16; x20 -= l4.y * x17; x20 -= l4.z * x18; x20 -= l4.w * x19; } __builtin_amdgcn_sched_barrier(0);
        float x21 = GDN_RHS(21); { const v4f l0 = GDN_L4(21, 0); const v4f l1 = GDN_L4(21, 1); const v4f l2 = GDN_L4(21, 2); const v4f l3 = GDN_L4(21, 3); const v4f l4 = GDN_L4(21, 4); const v4f l5 = GDN_L4(21, 5); __builtin_amdgcn_sched_barrier(0); x21 -= l0.x * x0; x21 -= l0.y * x1; x21 -= l0.z * x2; x21 -= l0.w * x3; x21 -= l1.x * x4; x21 -= l1.y * x5; x21 -= l1.z * x6; x21 -= l1.w * x7; x21 -= l2.x * x8; x21 -= l2.y * x9; x21 -= l2.z * x10; x21 -= l2.w * x11; x21 -= l3.x * x12; x21 -= l3.y * x13; x21 -= l3.z * x14; x21 -= l3.w * x15; x21 -= l4.x * x16; x21 -= l4.y * x17; x21 -= l4.z * x18; x21 -= l4.w * x19; x21 -= l5.x * x20; } __builtin_amdgcn_sched_barrier(0);
        float x22 = GDN_RHS(22); { const v4f l0 = GDN_L4(22, 0); const v4f l1 = GDN_L4(22, 1); const v4f l2 = GDN_L4(22, 2); const v4f l3 = GDN_L4(22, 3); const v4f l4 = GDN_L4(22, 4); const v4f l5 = GDN_L4(22, 5); __builtin_amdgcn_sched_barrier(0); x22 -= l0.x * x0; x22 -= l0.y * x1; x22 -= l0.z * x2; x22 -= l0.w * x3; x22 -= l1.x * x4; x22 -= l1.y * x5; x22 -= l1.z * x6; x22 -= l1.w * x7; x22 -= l2.x * x8; x22 -= l2.y * x9; x22 -= l2.z * x10; x22 -= l2.w * x11; x22 -= l3.x * x12; x22 -= l3.y * x13; x22 -= l3.z * x14; x22 -= l3.w * x15; x22 -= l4.x * x16; x22 -= l4.y * x17; x22 -= l4.z * x18; x22 -= l4.w * x19; x22 -= l5.x * x20; x22 -= l5.y * x21; } __builtin_amdgcn_sched_barrier(0);
        float x23 = GDN_RHS(23); { const v4f l0 = GDN_L4(23, 0); const v4f l1 = GDN_L4(23, 1); const v4f l2 = GDN_L4(23, 2); const v4f l3 = GDN_L4(23, 3); const v4f l4 = GDN_L4(23, 4); const v4f l5 = GDN_L4(23, 5); __builtin_amdgcn_sched_barrier(0); x23 -= l0.x * x0; x23 -= l0.y * x1; x23 -= l0.z * x2; x23 -= l0.w * x3; x23 -= l1.x * x4; x23 -= l1.y * x5; x23 -= l1.z * x6; x23 -= l1.w * x7; x23 -= l2.x * x8; x23 -= l2.y * x9; x23 -= l2.z * x10; x23 -= l2.w * x11; x23 -= l3.x * x12; x23 -= l3.y * x13; x23 -= l3.z * x14; x23 -= l3.w * x15; x23 -= l4.x * x16; x23 -= l4.y * x17; x23 -= l4.z * x18; x23 -= l4.w * x19; x23 -= l5.x * x20; x23 -= l5.y * x21; x23 -= l5.z * x22; } __builtin_amdgcn_sched_barrier(0);
        float x24 = GDN_RHS(24); { const v4f l0 = GDN_L4(24, 0); const v4f l1 = GDN_L4(24, 1); const v4f l2 = GDN_L4(24, 2); const v4f l3 = GDN_L4(24, 3); const v4f l4 = GDN_L4(24, 4); const v4f l5 = GDN_L4(24, 5); __builtin_amdgcn_sched_barrier(0); x24 -= l0.x * x0; x24 -= l0.y * x1; x24 -= l0.z * x2; x24 -= l0.w * x3; x24 -= l1.x * x4; x24 -= l1.y * x5; x24 -= l1.z * x6; x24 -= l1.w * x7; x24 -= l2.x * x8; x24 -= l2.y * x9; x24 -= l2.z * x10; x24 -= l2.w * x11; x24 -= l3.x * x12; x24 -= l3.y * x13; x24 -= l3.z * x14; x24 -= l3.w * x15; x24 -= l4.x * x16; x24 -= l4.y * x17; x24 -= l4.z * x18; x24 -= l4.w * x19; x24 -= l5.x * x20; x24 -= l5.y * x21; x24 -= l5.z * x22; x24 -= l5.w * x23; } __builtin_amdgcn_sched_barrier(0);
        float x25 = GDN_RHS(25); { const v4f l0 = GDN_L4(25, 0); const v4f l1 = GDN_L4(25, 1); const v4f l2 = GDN_L4(25, 2); const v4f l3 = GDN_L4(25, 3); const v4f l4 = GDN_L4(25, 4); const v4f l5 = GDN_L4(25, 5); __builtin_amdgcn_sched_barrier(0); x25 -= l0.x * x0; x25 -= l0.y * x1; x25 -= l0.z * x2; x25 -= l0.w * x3; x25 -= l1.x * x4; x25 -= l1.y * x5; x25 -= l1.z * x6; x25 -= l1.w * x7; x25 -= l2.x * x8; x25 -= l2.y * x9; x25 -= l2.z * x10; x25 -= l2.w * x11; x25 -= l3.x * x12; x25 -= l3.y * x13; x25 -= l3.z * x14; x25 -= l3.w * x15; x25 -= l4.x * x16; x25 -= l4.y * x17; x25 -= l4.z * x18; x25 -= l4.w * x19; x25 -= l5.x * x20; x25 -= l5.y * x21; x25 -= l5.z * x22; x25 -= l5.w * x23; } __builtin_amdgcn_sched_barrier(0); { const v4f l6 = GDN_L4(25, 6); __builtin_amdgcn_sched_barrier(0); x25 -= l6.x * x24; } __builtin_amdgcn_sched_barrier(0);
        float x26 = GDN_RHS(26); { const v4f l0 = GDN_L4(26, 0); const v4f l1 = GDN_L4(26, 1); const v4f l2 = GDN_L4(26, 2); const v4f l3 = GDN_L4(26, 3); const v4f l4 = GDN_L4(26, 4); const v4f l5 = GDN_L4(26, 5); __builtin_amdgcn_sched_barrier(0); x26 -= l0.x * x0; x26 -= l0.y * x1; x26 -= l0.z * x2; x26 -= l0.w * x3; x26 -= l1.x * x4; x26 -= l1.y * x5; x26 -= l1.z * x6; x26 -= l1.w * x7; x26 -= l2.x * x8; x26 -= l2.y * x9; x26 -= l2.z * x10; x26 -= l2.w * x11; x26 -= l3.x * x12; x26 -= l3.y * x13; x26 -= l3.z * x14; x26 -= l3.w * x15; x26 -= l4.x * x16; x26 -= l4.y * x17; x26 -= l4.z * x18; x26 -= l4.w * x19; x26 -= l5.x * x20; x26 -= l5.y * x21; x26 -= l5.z * x22; x26 -= l5.w * x23; } __builtin_amdgcn_sched_barrier(0); { const v4f l6 = GDN_L4(26, 6); __builtin_amdgcn_sched_barrier(0); x26 -= l6.x * x24; x26 -= l6.y * x25; } __builtin_amdgcn_sched_barrier(0);
        float x27 = GDN_RHS(27); { const v4f l0 = GDN_L4(27, 0); const v4f l1 = GDN_L4(27, 1); const v4f l2 = GDN_L4(27, 2); const v4f l3 = GDN_L4(27, 3); const v4f l4 = GDN_L4(27, 4); const v4f l5 = GDN_L4(27, 5); __builtin_amdgcn_sched_barrier(0); x27 -= l0.x * x0; x27 -= l0.y * x1; x27 -= l0.z * x2; x27 -= l0.w * x3; x27 -= l1.x * x4; x27 -= l1.y * x5; x27 -= l1.z * x6; x27 -= l1.w * x7; x27 -= l2.x * x8; x27 -= l2.y * x9; x27 -= l2.z * x10; x27 -= l2.w * x11; x27 -= l3.x * x12; x27 -= l3.y * x13; x27 -= l3.z * x14; x27 -= l3.w * x15; x27 -= l4.x * x16; x27 -= l4.y * x17; x27 -= l4.z * x18; x27 -= l4.w * x19; x27 -= l5.x * x20; x27 -= l5.y * x21; x27 -= l5.z * x22; x27 -= l5.w * x23; } __builtin_amdgcn_sched_barrier(0); { const v4f l6 = GDN_L4(27, 6); __builtin_amdgcn_sched_barrier(0); x27 -= l6.x * x24; x27 -= l6.y * x25; x27 -= l6.z * x26; } __builtin_amdgcn_sched_barrier(0);
        float x28 = GDN_RHS(28); { const v4f l0 = GDN_L4(28, 0); const v4f l1 = GDN_L4(28, 1); const v4f l2 = GDN_L4(28, 2); const v4f l3 = GDN_L4(28, 3); const v4f l4 = GDN_L4(28, 4); const v4f l5 = GDN_L4(28, 5); __builtin_amdgcn_sched_barrier(0); x28 -= l0.x * x0; x28 -= l0.y * x1; x28 -= l0.z * x2; x28 -= l0.w * x3; x28 -= l1.x * x4; x28 -= l1.y * x5; x28 -= l1.z * x6; x28 -= l1.w * x7; x28 -= l2.x * x8; x28 -= l2.y * x9; x28 -= l2.z * x10; x28 -= l2.w * x11; x28 -= l3.x * x12; x28 -= l3.y * x13; x28 -= l3.z * x14; x28 -= l3.w * x15; x28 -= l4.x * x16; x28 -= l4.y * x17; x28 -= l4.z * x18; x28 -= l4.w * x19; x28 -= l5.x * x20; x28 -= l5.y * x21; x28 -= l5.z * x22; x28 -= l5.w * x23; } __builtin_amdgcn_sched_barrier(0); { const v4f l6 = GDN_L4(28, 6); __builtin_amdgcn_sched_barrier(0); x28 -= l6.x * x24; x28 -= l6.y * x25; x28 -= l6.z * x26; x28 -= l6.w * x27; } __builtin_amdgcn_sched_barrier(0);
        float x29 = GDN_RHS(29); { const v4f l0 = GDN_L4(29, 0); const v4f l1 = GDN_L4(29, 1); const v4f l2 = GDN_L4(29, 2); const v4f l3 = GDN_L4(29, 3); const v4f l4 = GDN_L4(29, 4); const v4f l5 = GDN_L4(29, 5); __builtin_amdgcn_sched_barrier(0); x29 -= l0.x * x0; x29 -= l0.y * x1; x29 -= l0.z * x2; x29 -= l0.w * x3; x29 -= l1.x * x4; x29 -= l1.y * x5; x29 -= l1.z * x6; x29 -= l1.w * x7; x29 -= l2.x * x8; x29 -= l2.y * x9; x29 -= l2.z * x10; x29 -= l2.w * x11; x29 -= l3.x * x12; x29 -= l3.y * x13; x29 -= l3.z * x14; x29 -= l3.w * x15; x29 -= l4.x * x16; x29 -= l4.y * x17; x29 -= l4.z * x18; x29 -= l4.w * x19; x29 -= l5.x * x20; x29 -= l5.y * x21; x29 -= l5.z * x22; x29 -= l5.w * x23; } __builtin_amdgcn_sched_barrier(0); { const v4f l6 = GDN_L4(29, 6); const v4f l7 = GDN_L4(29, 7); __builtin_amdgcn_sched_barrier(0); x29 -= l6.x * x24; x29 -= l6.y * x25; x29 -= l6.z * x26; x29 -= l6.w * x27; x29 -= l7.x * x28; } __builtin_amdgcn_sched_barrier(0);
        float x30 = GDN_RHS(30); { const v4f l0 = GDN_L4(30, 0); const v4f l1 = GDN_L4(30, 1); const v4f l2 = GDN_L4(30, 2); const v4f l3 = GDN_L4(30, 3); const v4f l4 = GDN_L4(30, 4); const v4f l5 = GDN_L4(30, 5); __builtin_amdgcn_sched_barrier(0); x30 -= l0.x * x0; x30 -= l0.y * x1; x30 -= l0.z * x2; x30 -= l0.w * x3; x30 -= l1.x * x4; x30 -= l1.y * x5; x30 -= l1.z * x6; x30 -= l1.w * x7; x30 -= l2.x * x8; x30 -= l2.y * x9; x30 -= l2.z * x10; x30 -= l2.w * x11; x30 -= l3.x * x12; x30 -= l3.y * x13; x30 -= l3.z * x14; x30 -= l3.w * x15; x30 -= l4.x * x16; x30 -= l4.y * x17; x30 -= l4.z * x18; x30 -= l4.w * x19; x30 -= l5.x * x20; x30 -= l5.y * x21; x30 -= l5.z * x22; x30 -= l5.w * x23; } __builtin_amdgcn_sched_barrier(0); { const v4f l6 = GDN_L4(30, 6); const v4f l7 = GDN_L4(30, 7); __builtin_amdgcn_sched_barrier(0); x30 -= l6.x * x24; x30 -= l6.y * x25; x30 -= l6.z * x26; x30 -= l6.w * x27; x30 -= l7.x * x28; x30 -= l7.y * x29; } __builtin_amdgcn_sched_barrier(0);
        float x31 = GDN_RHS(31); { const v4f l0 = GDN_L4(31, 0); const v4f l1 = GDN_L4(31, 1); const v4f l2 = GDN_L4(31, 2); const v4f l3 = GDN_L4(31, 3); const v4f l4 = GDN_L4(31, 4); const v4f l5 = GDN_L4(31, 5); __builtin_amdgcn_sched_barrier(0); x31 -= l0.x * x0; x31 -= l0.y * x1; x31 -= l0.z * x2; x31 -= l0.w * x3; x31 -= l1.x * x4; x31 -= l1.y * x5; x31 -= l1.z * x6; x31 -= l1.w * x7; x31 -= l2.x * x8; x31 -= l2.y * x9; x31 -= l2.z * x10; x31 -= l2.w * x11; x31 -= l3.x * x12; x31 -= l3.y * x13; x31 -= l3.z * x14; x31 -= l3.w * x15; x31 -= l4.x * x16; x31 -= l4.y * x17; x31 -= l4.z * x18; x31 -= l4.w * x19; x31 -= l5.x * x20; x31 -= l5.y * x21; x31 -= l5.z * x22; x31 -= l5.w * x23; } __builtin_amdgcn_sched_barrier(0); { const v4f l6 = GDN_L4(31, 6); const v4f l7 = GDN_L4(31, 7); __builtin_amdgcn_sched_barrier(0); x31 -= l6.x * x24; x31 -= l6.y * x25; x31 -= l6.z * x26; x31 -= l6.w * x27; x31 -= l7.x * x28; x31 -= l7.y * x29; x31 -= l7.z * x30; } __builtin_amdgcn_sched_barrier(0);
        float x32 = GDN_RHS(32); { const v4f l0 = GDN_L4(32, 0); const v4f l1 = GDN_L4(32, 1); const v4f l2 = GDN_L4(32, 2); const v4f l3 = GDN_L4(32, 3); const v4f l4 = GDN_L4(32, 4); const v4f l5 = GDN_L4(32, 5); __builtin_amdgcn_sched_barrier(0); x32 -= l0.x * x0; x32 -= l0.y * x1; x32 -= l0.z * x2; x32 -= l0.w * x3; x32 -= l1.x * x4; x32 -= l1.y * x5; x32 -= l1.z * x6; x32 -= l1.w * x7; x32 -= l2.x * x8; x32 -= l2.y * x9; x32 -= l2.z * x10; x32 -= l2.w * x11; x32 -= l3.x * x12; x32 -= l3.y * x13; x32 -= l3.z * x14; x32 -= l3.w * x15; x32 -= l4.x * x16; x32 -= l4.y * x17; x32 -= l4.z * x18; x32 -= l4.w * x19; x32 -= l5.x * x20; x32 -= l5.y * x21; x32 -= l5.z * x22; x32 -= l5.w * x23; } __builtin_amdgcn_sched_barrier(0); { const v4f l6 = GDN_L4(32, 6); const v4f l7 = GDN_L4(32, 7); __builtin_amdgcn_sched_barrier(0); x32 -= l6.x * x24; x32 -= l6.y * x25; x32 -= l6.z * x26; x32 -= l6.w * x27; x32 -= l7.x * x28; x32 -= l7.y * x29; x32 -= l7.z * x30; x32 -= l7.w * x31; } __builtin_amdgcn_sched_barrier(0);
        float x33 = GDN_RHS(33); { const v4f l0 = GDN_L4(33, 0); const v4f l1 = GDN_L4(33, 1); const v4f l2 = GDN_L4(33, 2); const v4f l3 = GDN_L4(33, 3); const v4f l4 = GDN_L4(33, 4); const v4f l5 = GDN_L4(33, 5); __builtin_amdgcn_sched_barrier(0); x33 -= l0.x * x0; x33 -= l0.y * x1; x33 -= l0.z * x2; x33 -= l0.w * x3; x33 -= l1.x * x4; x33 -= l1.y * x5; x33 -= l1.z * x6; x33 -= l1.w * x7; x33 -= l2.x * x8; x33 -= l2.y * x9; x33 -= l2.z * x10; x33 -= l2.w * x11; x33 -= l3.x * x12; x33 -= l3.y * x13; x33 -= l3.z * x14; x33 -= l3.w * x15; x33 -= l4.x * x16; x33 -= l4.y * x17; x33 -= l4.z * x18; x33 -= l4.w * x19; x33 -= l5.x * x20; x33 -= l5.y * x21; x33 -= l5.z * x22; x33 -= l5.w * x23; } __builtin_amdgcn_sched_barrier(0); { const v4f l6 = GDN_L4(33, 6); const v4f l7 = GDN_L4(33, 7); const v4f l8 = GDN_L4(33, 8); __builtin_amdgcn_sched_barrier(0); x33 -= l6.x * x24; x33 -= l6.y * x25; x33 -= l6.z * x26; x33 -= l6.w * x27; x33 -= l7.x * x28; x33 -= l7.y * x29; x33 -= l7.z * x30; x33 -= l7.w * x31; x33 -= l8.x * x32; } __builtin_amdgcn_sched_barrier(0);
        float x34 = GDN_RHS(34); { const v4f l0 = GDN_L4(34, 0); const v4f l1 = GDN_L4(34, 1); const v4f l2 = GDN_L4(34, 2); const v4f l3 = GDN_L4(34, 3); const v4f l4 = GDN_L4(34, 4); const v4f l5 = GDN_L4(34, 5); __builtin_amdgcn_sched_barrier(0); x34 -= l0.x * x0; x34 -= l0.y * x1; x34 -= l0.z * x2; x34 -= l0.w * x3; x34 -= l1.x * x4; x34 -= l1.y * x5; x34 -= l1.z * x6; x34 -= l1.w * x7; x34 -= l2.x * x8; x34 -= l2.y * x9; x34 -= l2.z * x10; x34 -= l2.w * x11; x34 -= l3.x * x12; x34 -= l3.y * x13; x34 -= l3.z * x14; x34 -= l3.w * x15; x34 -= l4.x * x16; x34 -= l4.y * x17; x34 -= l4.z * x18; x34 -= l4.w * x19; x34 -= l5.x * x20; x34 -= l5.y * x21; x34 -= l5.z * x22; x34 -= l5.w * x23; } __builtin_amdgcn_sched_barrier(0); { const v4f l6 = GDN_L4(34, 6); const v4f l7 = GDN_L4(34, 7); const v4f l8 = GDN_L4(34, 8); __builtin_amdgcn_sched_barrier(0); x34 -= l6.x * x24; x34 -= l6.y * x25; x34 -= l6.z * x26; x34 -= l6.w * x27; x34 -= l7.x * x28; x34 -= l7.y * x29; x34 -= l7.z * x30; x34 -= l7.w * x31; x34 -= l8.x * x32; x34 -= l8.y * x33; } __builtin_amdgcn_sched_barrier(0);
        float x35 = GDN_RHS(35); { const v4f l0 = GDN_L4(35, 0); const v4f l1 = GDN_L4(35, 1); const v4f l2 = GDN_L4(35, 2); const v4f l3 = GDN_L4(35, 3); const v4f l4 = GDN_L4(35, 4); const v4f l5 = GDN_L4(35, 5); __builtin_amdgcn_sched_barrier(0); x35 -= l0.x * x0; x35 -= l0.y * x1; x35 -= l0.z * x2; x35 -= l0.w * x3; x35 -= l1.x * x4; x35 -= l1.y * x5; x35 -= l1.z * x6; x35 -= l1.w * x7; x35 -= l2.x * x8; x35 -= l2.y * x9; x35 -= l2.z * x10; x35 -= l2.w * x11; x35 -= l3.x * x12; x35 -= l3.y * x13; x35 -= l3.z * x14; x35 -= l3.w * x15; x35 -= l4.x * x16; x35 -= l4.y * x17; x35 -= l4.z * x18; x35 -= l4.w * x19; x35 -= l5.x * x20; x35 -= l5.y * x21; x35 -= l5.z * x22; x35 -= l5.w * x23; } __builtin_amdgcn_sched_barrier(0); { const v4f l6 = GDN_L4(35, 6); const v4f l7 = GDN_L4(35, 7); const v4f l8 = GDN_L4(35, 8); __builtin_amdgcn_sched_barrier(0); x35 -= l6.x * x24; x35 -= l6.y * x25; x35 -= l6.z * x26; x35 -= l6.w * x27; x35 -= l7.x * x28; x35 -= l7.y * x29; x35 -= l7.z * x30; x35 -= l7.w * x31; x35 -= l8.x * x32; x35 -= l8.y * x33; x35 -= l8.z * x34; } __builtin_amdgcn_sched_barrier(0);
        float x36 = GDN_RHS(36); { const v4f l0 = GDN_L4(36, 0); const v4f l1 = GDN_L4(36, 1); const v4f l2 = GDN_L4(36, 2); const v4f l3 = GDN_L4(36, 3); const v4f l4 = GDN_L4(36, 4); const v4f l5 = GDN_L4(36, 5); __builtin_amdgcn_sched_barrier(0); x36 -= l0.x * x0; x36 -= l0.y * x1; x36 -= l0.z * x2; x36 -= l0.w * x3; x36 -= l1.x * x4; x36 -= l1.y * x5; x36 -= l1.z * x6; x36 -= l1.w * x7; x36 -= l2.x * x8; x36 -= l2.y * x9; x36 -= l2.z * x10; x36 -= l2.w * x11; x36 -= l3.x * x12; x36 -= l3.y * x13; x36 -= l3.z * x14; x36 -= l3.w * x15; x36 -= l4.x * x16; x36 -= l4.y * x17; x36 -= l4.z * x18; x36 -= l4.w * x19; x36 -= l5.x * x20; x36 -= l5.y * x21; x36 -= l5.z * x22; x36 -= l5.w * x23; } __builtin_amdgcn_sched_barrier(0); { const v4f l6 = GDN_L4(36, 6); const v4f l7 = GDN_L4(36, 7); const v4f l8 = GDN_L4(36, 8); __builtin_amdgcn_sched_barrier(0); x36 -= l6.x * x24; x36 -= l6.y * x25; x36 -= l6.z * x26; x36 -= l6.w * x27; x36 -= l7.x * x28; x36 -= l7.y * x29; x36 -= l7.z * x30; x36 -= l7.w * x31; x36 -= l8.x * x32; x36 -= l8.y * x33; x36 -= l8.z * x34; x36 -= l8.w * x35; } __builtin_amdgcn_sched_barrier(0);
        float x37 = GDN_RHS(37); { const v4f l0 = GDN_L4(37, 0); const v4f l1 = GDN_L4(37, 1); const v4f l2 = GDN_L4(37, 2); const v4f l3 = GDN_L4(37, 3); const v4f l4 = GDN_L4(37, 4); const v4f l5 = GDN_L4(37, 5); __builtin_amdgcn_sched_barrier(0); x37 -= l0.x * x0; x37 -= l0.y * x1; x37 -= l0.z * x2; x37 -= l0.w * x3; x37 -= l1.x * x4; x37 -= l1.y * x5; x37 -= l1.z * x6; x37 -= l1.w * x7; x37 -= l2.x * x8; x37 -= l2.y * x9; x37 -= l2.z * x10; x37 -= l2.w * x11; x37 -= l3.x * x12; x37 -= l3.y * x13; x37 -= l3.z * x14; x37 -= l3.w * x15; x37 -= l4.x * x16; x37 -= l4.y * x17; x37 -= l4.z * x18; x37 -= l4.w * x19; x37 -= l5.x * x20; x37 -= l5.y * x21; x37 -= l5.z * x22; x37 -= l5.w * x23; } __builtin_amdgcn_sched_barrier(0); { const v4f l6 = GDN_L4(37, 6); const v4f l7 = GDN_L4(37, 7); const v4f l8 = GDN_L4(37, 8); const v4f l9 = GDN_L4(37, 9); __builtin_amdgcn_sched_barrier(0); x37 -= l6.x * x24; x37 -= l6.y * x25; x37 -= l6.z * x26; x37 -= l6.w * x27; x37 -= l7.x * x28; x37 -= l7.y * x29; x37 -= l7.z * x30; x37 -= l7.w * x31; x37 -= l8.x * x32; x37 -= l8.y * x33; x37 -= l8.z * x34; x37 -= l8.w * x35; x37 -= l9.x * x36; } __builtin_amdgcn_sched_barrier(0);
        float x38 = GDN_RHS(38); { const v4f l0 = GDN_L4(38, 0); const v4f l1 = GDN_L4(38, 1); const v4f l2 = GDN_L4(38, 2); const v4f l3 = GDN_L4(38, 3); const v4f l4 = GDN_L4(38, 4); const v4f l5 = GDN_L4(38, 5); __builtin_amdgcn_sched_barrier(0); x38 -= l0.x * x0; x38 -= l0.y * x1; x38 -= l0.z * x2; x38 -= l0.w * x3; x38 -= l1.x * x4; x38 -= l1.y * x5; x38 -= l1.z * x6; x38 -= l1.w * x7; x38 -= l2.x * x8; x38 -= l2.y * x9; x38 -= l2.z * x10; x38 -= l2.w * x11; x38 -= l3.x * x12; x38 -= l3.y * x13; x38 -= l3.z * x14; x38 -= l3.w * x15; x38 -= l4.x * x16; x38 -= l4.y * x17; x38 -= l4.z * x18; x38 -= l4.w * x19; x38 -= l5.x * x20; x38 -= l5.y * x21; x38 -= l5.z * x22; x38 -= l5.w * x23; } __builtin_amdgcn_sched_barrier(0); { const v4f l6 = GDN_L4(38, 6); const v4f l7 = GDN_L4(38, 7); const v4f l8 = GDN_L4(38, 8); const v4f l9 = GDN_L4(38, 9); __builtin_amdgcn_sched_barrier(0); x38 -= l6.x * x24; x38 -= l6.y * x25; x38 -= l6.z * x26; x38 -= l6.w * x27; x38 -= l7.x * x28; x38 -= l7.y * x29; x38 -= l7.z * x30; x38 -= l7.w * x31; x38 -= l8.x * x32; x38 -= l8.y * x33; x38 -= l8.z * x34; x38 -= l8.w * x35; x38 -= l9.x * x36; x38 -= l9.y * x37; } __builtin_amdgcn_sched_barrier(0);
        float x39 = GDN_RHS(39); { const v4f l0 = GDN_L4(39, 0); const v4f l1 = GDN_L4(39, 1); const v4f l2 = GDN_L4(39, 2); const v4f l3 = GDN_L4(39, 3); const v4f l4 = GDN_L4(39, 4); const v4f l5 = GDN_L4(39, 5); __builtin_amdgcn_sched_barrier(0); x39 -= l0.x * x0; x39 -= l0.y * x1; x39 -= l0.z * x2; x39 -= l0.w * x3; x39 -= l1.x * x4; x39 -= l1.y * x5; x39 -= l1.z * x6; x39 -= l1.w * x7; x39 -= l2.x * x8; x39 -= l2.y * x9; x39 -= l2.z * x10; x39 -= l2.w * x11; x39 -= l3.x * x12; x39 -= l3.y * x13; x39 -= l3.z * x14; x39 -= l3.w * x15; x39 -= l4.x * x16; x39 -= l4.y * x17; x39 -= l4.z * x18; x39 -= l4.w * x19; x39 -= l5.x * x20; x39 -= l5.y * x21; x39 -= l5.z * x22; x39 -= l5.w * x23; } __builtin_amdgcn_sched_barrier(0); { const v4f l6 = GDN_L4(39, 6); const v4f l7 = GDN_L4(39, 7); const v4f l8 = GDN_L4(39, 8); const v4f l9 = GDN_L4(39, 9); __builtin_amdgcn_sched_barrier(0); x39 -= l6.x * x24; x39 -= l6.y * x25; x39 -= l6.z * x26; x39 -= l6.w * x27; x39 -= l7.x * x28; x39 -= l7.y * x29; x39 -= l7.z * x30; x39 -= l7.w * x31; x39 -= l8.x * x32; x39 -= l8.y * x33; x39 -= l8.z * x34; x39 -= l8.w * x35; x39 -= l9.x * x36; x39 -= l9.y * x37; x39 -= l9.z * x38; } __builtin_amdgcn_sched_barrier(0);
        float x40 = GDN_RHS(40); { const v4f l0 = GDN_L4(40, 0); const v4f l1 = GDN_L4(40, 1); const v4f l2 = GDN_L4(40, 2); const v4f l3 = GDN_L4(40, 3); const v4f l4 = GDN_L4(40, 4); const v4f l5 = GDN_L4(40, 5); __builtin_amdgcn_sched_barrier(0); x40 -= l0.x * x0; x40 -= l0.y * x1; x40 -= l0.z * x2; x40 -= l0.w * x3; x40 -= l1.x * x4; x40 -= l1.y * x5; x40 -= l1.z * x6; x40 -= l1.w * x7; x40 -= l2.x * x8; x40 -= l2.y * x9; x40 -= l2.z * x10; x40 -= l2.w * x11; x40 -= l3.x * x12; x40 -= l3.y * x13; x40 -= l3.z * x14; x40 -= l3.w * x15; x40 -= l4.x * x16; x40 -= l4.y * x17; x40 -= l4.z * x18; x40 -= l4.w * x19; x40 -= l5.x * x20; x40 -= l5.y * x21; x40 -= l5.z * x22; x40 -= l5.w * x23; } __builtin_amdgcn_sched_barrier(0); { const v4f l6 = GDN_L4(40, 6); const v4f l7 = GDN_L4(40, 7); const v4f l8 = GDN_L4(40, 8); const v4f l9 = GDN_L4(40, 9); __builtin_amdgcn_sched_barrier(0); x40 -= l6.x * x24; x40 -= l6.y * x25; x40 -= l6.z * x26; x40 -= l6.w * x27; x40 -= l7.x * x28; x40 -= l7.y * x29; x40 -= l7.z * x30; x40 -= l7.w * x31; x40 -= l8.x * x32; x40 -= l8.y * x33; x40 -= l8.z * x34; x40 -= l8.w * x35; x40 -= l9.x * x36; x40 -= l9.y * x37; x40 -= l9.z * x38; x40 -= l9.w * x39; } __builtin_amdgcn_sched_barrier(0);
        float x41 = GDN_RHS(41); { const v4f l0 = GDN_L4(41, 0); const v4f l1 = GDN_L4(41, 1); const v4f l2 = GDN_L4(41, 2); const v4f l3 = GDN_L4(41, 3); const v4f l4 = GDN_L4(41, 4); const v4f l5 = GDN_L4(41, 5); __builtin_amdgcn_sched_barrier(0); x41 -= l0.x * x0; x41 -= l0.y * x1; x41 -= l0.z * x2; x41 -= l0.w * x3; x41 -= l1.x * x4; x41 -= l1.y * x5; x41 -= l1.z * x6; x41 -= l1.w * x7; x41 -= l2.x * x8; x41 -= l2.y * x9; x41 -= l2.z * x10; x41 -= l2.w * x11; x41 -= l3.x * x12; x41 -= l3.y * x13; x41 -= l3.z * x14; x41 -= l3.w * x15; x41 -= l4.x * x16; x41 -= l4.y * x17; x41 -= l4.z * x18; x41 -= l4.w * x19; x41 -= l5.x * x20; x41 -= l5.y * x21; x41 -= l5.z * x22; x41 -= l5.w * x23; } __builtin_amdgcn_sched_barrier(0); { const v4f l6 = GDN_L4(41, 6); const v4f l7 = GDN_L4(41, 7); const v4f l8 = GDN_L4(41, 8); const v4f l9 = GDN_L4(41, 9); const v4f l10 = GDN_L4(41, 10); __builtin_amdgcn_sched_barrier(0); x41 -= l6.x * x24; x41 -= l6.y * x25; x41 -= l6.z * x26; x41 -= l6.w * x27; x41 -= l7.x * x28; x41 -= l7.y * x29; x41 -= l7.z * x30; x41 -= l7.w * x31; x41 -= l8.x * x32; x41 -= l8.y * x33; x41 -= l8.z * x34; x41 -= l8.w * x35; x41 -= l9.x * x36; x41 -= l9.y * x37; x41 -= l9.z * x38; x41 -= l9.w * x39; x41 -= l10.x * x40; } __builtin_amdgcn_sched_barrier(0);
        float x42 = GDN_RHS(42); { const v4f l0 = GDN_L4(42, 0); const v4f l1 = GDN_L4(42, 1); const v4f l2 = GDN_L4(42, 2); const v4f l3 = GDN_L4(42, 3); const v4f l4 = GDN_L4(42, 4); const v4f l5 = GDN_L4(42, 5); __builtin_amdgcn_sched_barrier(0); x42 -= l0.x * x0; x42 -= l0.y * x1; x42 -= l0.z * x2; x42 -= l0.w * x3; x42 -= l1.x * x4; x42 -= l1.y * x5; x42 -= l1.z * x6; x42 -= l1.w * x7; x42 -= l2.x * x8; x42 -= l2.y * x9; x42 -= l2.z * x10; x42 -= l2.w * x11; x42 -= l3.x * x12; x42 -= l3.y * x13; x42 -= l3.z * x14; x42 -= l3.w * x15; x42 -= l4.x * x16; x42 -= l4.y * x17; x42 -= l4.z * x18; x42 -= l4.w * x19; x42 -= l5.x * x20; x42 -= l5.y * x21; x42 -= l5.z * x22; x42 -= l5.w * x23; } __builtin_amdgcn_sched_barrier(0); { const v4f l6 = GDN_L4(42, 6); const v4f l7 = GDN_L4(42, 7); const v4f l8 = GDN_L4(42, 8); const v4f l9 = GDN_L4(42, 9); const v4f l10 = GDN_L4(42, 10); __builtin_amdgcn_sched_barrier(0); x42 -= l6.x * x24; x42 -= l6.y * x25; x42 -= l6.z * x26; x42 -= l6.w * x27; x42 -= l7.x * x28; x42 -= l7.y * x29; x42 -= l7.z * x30; x42 -= l7.w * x31; x42 -= l8.x * x32; x42 -= l8.y * x33; x42 -= l8.z * x34; x42 -= l8.w * x35; x42 -= l9.x * x36; x42 -= l9.y * x37; x42 -= l9.z * x38; x42 -= l9.w * x39; x42 -= l10.x * x40; x42 -= l10.y * x41; } __builtin_amdgcn_sched_barrier(0);
        float x43 = GDN_RHS(43); { const v4f l0 = GDN_L4(43, 0); const v4f l1 = GDN_L4(43, 1); const v4f l2 = GDN_L4(43, 2); const v4f l3 = GDN_L4(43, 3); const v4f l4 = GDN_L4(43, 4); const v4f l5 = GDN_L4(43, 5); __builtin_amdgcn_sched_barrier(0); x43 -= l0.x * x0; x43 -= l0.y * x1; x43 -= l0.z * x2; x43 -= l0.w * x3; x43 -= l1.x * x4; x43 -= l1.y * x5; x43 -= l1.z * x6; x43 -= l1.w * x7; x43 -= l2.x * x8; x43 -= l2.y * x9; x43 -= l2.z * x10; x43 -= l2.w * x11; x43 -= l3.x * x12; x43 -= l3.y * x13; x43 -= l3.z * x14; x43 -= l3.w * x15; x43 -= l4.x * x16; x43 -= l4.y * x17; x43 -= l4.z * x18; x43 -= l4.w * x19; x43 -= l5.x * x20; x43 -= l5.y * x21; x43 -= l5.z * x22; x43 -= l5.w * x23; } __builtin_amdgcn_sched_barrier(0); { const v4f l6 = GDN_L4(43, 6); const v4f l7 = GDN_L4(43, 7); const v4f l8 = GDN_L4(43, 8); const v4f l9 = GDN_L4(43, 9); const v4f l10 = GDN_L4(43, 10); __builtin_amdgcn_sched_barrier(0); x43 -= l6.x * x24; x43 -= l6.y * x25; x43 -= l6.z * x26; x43 -= l6.w * x27; x43 -= l7.x * x28; x43 -= l7.y * x29; x43 -= l7.z * x30; x43 -= l7.w * x31; x43 -= l8.x * x32; x43 -= l8.y * x33; x43 -= l8.z * x34; x43 -= l8.w * x35; x43 -= l9.x * x36; x43 -= l9.y * x37; x43 -= l9.z * x38; x43 -= l9.w * x39; x43 -= l10.x * x40; x43 -= l10.y * x41; x43 -= l10.z * x42; } __builtin_amdgcn_sched_barrier(0);
        float x44 = GDN_RHS(44); { const v4f l0 = GDN_L4(44, 0); const v4f l1 = GDN_L4(44, 1); const v4f l2 = GDN_L4(44, 2); const v4f l3 = GDN_L4(44, 3); const v4f l4 = GDN_L4(44, 4); const v4f l5 = GDN_L4(44, 5); __builtin_amdgcn_sched_barrier(0); x44 -= l0.x * x0; x44 -= l0.y * x1; x44 -= l0.z * x2; x44 -= l0.w * x3; x44 -= l1.x * x4; x44 -= l1.y * x5; x44 -= l1.z * x6; x44 -= l1.w * x7; x44 -= l2.x * x8; x44 -= l2.y * x9; x44 -= l2.z * x10; x44 -= l2.w * x11; x44 -= l3.x * x12; x44 -= l3.y * x13; x44 -= l3.z * x14; x44 -= l3.w * x15; x44 -= l4.x * x16; x44 -= l4.y * x17; x44 -= l4.z * x18; x44 -= l4.w * x19; x44 -= l5.x * x20; x44 -= l5.y * x21; x44 -= l5.z * x22; x44 -= l5.w * x23; } __builtin_amdgcn_sched_barrier(0); { const v4f l6 = GDN_L4(44, 6); const v4f l7 = GDN_L4(44, 7); const v4f l8 = GDN_L4(44, 8); const v4f l9 = GDN_L4(44, 9); const v4f l10 = GDN_L4(44, 10); __builtin_amdgcn_sched_barrier(0); x44 -= l6.x * x24; x44 -= l6.y * x25; x44 -= l6.z * x26; x44 -= l6.w * x27; x44 -= l7.x * x28; x44 -= l7.y * x29; x44 -= l7.z * x30; x44 -= l7.w * x31; x44 -= l8.x * x32; x44 -= l8.y * x33; x44 -= l8.z * x34; x44 -= l8.w * x35; x44 -= l9.x * x36; x44 -= l9.y * x37; x44 -= l9.z * x38; x44 -= l9.w * x39; x44 -= l10.x * x40; x44 -= l10.y * x41; x44 -= l10.z * x42; x44 -= l10.w * x43; } __builtin_amdgcn_sched_barrier(0);
        float x45 = GDN_RHS(45); { const v4f l0 = GDN_L4(45, 0); const v4f l1 = GDN_L4(45, 1); const v4f l2 = GDN_L4(45, 2); const v4f l3 = GDN_L4(45, 3); const v4f l4 = GDN_L4(45, 4); const v4f l5 = GDN_L4(45, 5); __builtin_amdgcn_sched_barrier(0); x45 -= l0.x * x0; x45 -= l0.y * x1; x45 -= l0.z * x2; x45 -= l0.w * x3; x45 -= l1.x * x4; x45 -= l1.y * x5; x45 -= l1.z * x6; x45 -= l1.w * x7; x45 -= l2.x * x8; x45 -= l2.y * x9; x45 -= l2.z * x10; x45 -= l2.w * x11; x45 -= l3.x * x12; x45 -= l3.y * x13; x45 -= l3.z * x14; x45 -= l3.w * x15; x45 -= l4.x * x16; x45 -= l4.y * x17; x45 -= l4.z * x18; x45 -= l4.w * x19; x45 -= l5.x * x20; x45 -= l5.y * x21; x45 -= l5.z * x22; x45 -= l5.w * x23; } __builtin_amdgcn_sched_barrier(0); { const v4f l6 = GDN_L4(45, 6); const v4f l7 = GDN_L4(45, 7); const v4f l8 = GDN_L4(45, 8); const v4f l9 = GDN_L4(45, 9); const v4f l10 = GDN_L4(45, 10); const v4f l11 = GDN_L4(45, 11); __builtin_amdgcn_sched_barrier(0); x45 -= l6.x * x24; x45 -= l6.y * x25; x45 -= l6.z * x26; x45 -= l6.w * x27; x45 -= l7.x * x28; x45 -= l7.y * x29; x45 -= l7.z * x30; x45 -= l7.w * x31; x45 -= l8.x * x32; x45 -= l8.y * x33; x45 -= l8.z * x34; x45 -= l8.w * x35; x45 -= l9.x * x36; x45 -= l9.y * x37; x45 -= l9.z * x38; x45 -= l9.w * x39; x45 -= l10.x * x40; x45 -= l10.y * x41; x45 -= l10.z * x42; x45 -= l10.w * x43; x45 -= l11.x * x44; } __builtin_amdgcn_sched_barrier(0);
        float x46 = GDN_RHS(46); { const v4f l0 = GDN_L4(46, 0); const v4f l1 = GDN_L4(46, 1); const v4f l2 = GDN_L4(46, 2); const v4f l3 = GDN_L4(46, 3); const v4f l4 = GDN_L4(46, 4); const v4f l5 = GDN_L4(46, 5); __builtin_amdgcn_sched_barrier(0); x46 -= l0.x * x0; x46 -= l0.y * x1; x46 -= l0.z * x2; x46 -= l0.w * x3; x46 -= l1.x * x4; x46 -= l1.y * x5; x46 -= l1.z * x6; x46 -= l1.w * x7; x46 -= l2.x * x8; x46 -= l2.y * x9; x46 -= l2.z * x10; x46 -= l2.w * x11; x46 -= l3.x * x12; x46 -= l3.y * x13; x46 -= l3.z * x14; x46 -= l3.w * x15; x46 -= l4.x * x16; x46 -= l4.y * x17; x46 -= l4.z * x18; x46 -= l4.w * x19; x46 -= l5.x * x20; x46 -= l5.y * x21; x46 -= l5.z * x22; x46 -= l5.w * x23; } __builtin_amdgcn_sched_barrier(0); { const v4f l6 = GDN_L4(46, 6); const v4f l7 = GDN_L4(46, 7); const v4f l8 = GDN_L4(46, 8); const v4f l9 = GDN_L4(46, 9); const v4f l10 = GDN_L4(46, 10); const v4f l11 = GDN_L4(46, 11); __builtin_amdgcn_sched_barrier(0); x46 -= l6.x * x24; x46 -= l6.y * x25; x46 -= l6.z * x26; x46 -= l6.w * x27; x46 -= l7.x * x28; x46 -= l7.y * x29; x46 -= l7.z * x30; x46 -= l7.w * x31; x46 -= l8.x * x32; x46 -= l8.y * x33; x46 -= l8.z * x34; x46 -= l8.w * x35; x46 -= l9.x * x36; x46 -= l9.y * x37; x46 -= l9.z * x38; x46 -= l9.w * x39; x46 -= l10.x * x40; x46 -= l10.y * x41; x46 -= l10.z * x42; x46 -= l10.w * x43; x46 -= l11.x * x44; x46 -= l11.y * x45; } __builtin_amdgcn_sched_barrier(0);
        float x47 = GDN_RHS(47); { const v4f l0 = GDN_L4(47, 0); const v4f l1 = GDN_L4(47, 1); const v4f l2 = GDN_L4(47, 2); const v4f l3 = GDN_L4(47, 3); const v4f l4 = GDN_L4(47, 4); const v4f l5 = GDN_L4(47, 5); __builtin_amdgcn_sched_barrier(0); x47 -= l0.x * x0; x47 -= l0.y * x1; x47 -= l0.z * x2; x47 -= l0.w * x3; x47 -= l1.x * x4; x47 -= l1.y * x5; x47 -= l1.z * x6; x47 -= l1.w * x7; x47 -= l2.x * x8; x47 -= l2.y * x9; x47 -= l2.z * x10; x47 -= l2.w * x11; x47 -= l3.x * x12; x47 -= l3.y * x13; x47 -= l3.z * x14; x47 -= l3.w * x15; x47 -= l4.x * x16; x47 -= l4.y * x17; x47 -= l4.z * x18; x47 -= l4.w * x19; x47 -= l5.x * x20; x47 -= l5.y * x21; x47 -= l5.z * x22; x47 -= l5.w * x23; } __builtin_amdgcn_sched_barrier(0); { const v4f l6 = GDN_L4(47, 6); const v4f l7 = GDN_L4(47, 7); const v4f l8 = GDN_L4(47, 8); const v4f l9 = GDN_L4(47, 9); const v4f l10 = GDN_L4(47, 10); const v4f l11 = GDN_L4(47, 11); __builtin_amdgcn_sched_barrier(0); x47 -= l6.x * x24; x47 -= l6.y * x25; x47 -= l6.z * x26; x47 -= l6.w * x27; x47 -= l7.x * x28; x47 -= l7.y * x29; x47 -= l7.z * x30; x47 -= l7.w * x31; x47 -= l8.x * x32; x47 -= l8.y * x33; x47 -= l8.z * x34; x47 -= l8.w * x35; x47 -= l9.x * x36; x47 -= l9.y * x37; x47 -= l9.z * x38; x47 -= l9.w * x39; x47 -= l10.x * x40; x47 -= l10.y * x41; x47 -= l10.z * x42; x47 -= l10.w * x43; x47 -= l11.x * x44; x47 -= l11.y * x45; x47 -= l11.z * x46; } __builtin_amdgcn_sched_barrier(0);
        float x48 = GDN_RHS(48); { const v4f l0 = GDN_L4(48, 0); const v4f l1 = GDN_L4(48, 1); const v4f l2 = GDN_L4(48, 2); const v4f l3 = GDN_L4(48, 3); const v4f l4 = GDN_L4(48, 4); const v4f l5 = GDN_L4(48, 5); __builtin_amdgcn_sched_barrier(0); x48 -= l0.x * x0; x48 -= l0.y * x1; x48 -= l0.z * x2; x48 -= l0.w * x3; x48 -= l1.x * x4; x48 -= l1.y * x5; x48 -= l1.z * x6; x48 -= l1.w * x7; x48 -= l2.x * x8; x48 -= l2.y * x9; x48 -= l2.z * x10; x48 -= l2.w * x11; x48 -= l3.x * x12; x48 -= l3.y * x13; x48 -= l3.z * x14; x48 -= l3.w * x15; x48 -= l4.x * x16; x48 -= l4.y * x17; x48 -= l4.z * x18; x48 -= l4.w * x19; x48 -= l5.x * x20; x48 -= l5.y * x21; x48 -= l5.z * x22; x48 -= l5.w * x23; } __builtin_amdgcn_sched_barrier(0); { const v4f l6 = GDN_L4(48, 6); const v4f l7 = GDN_L4(48, 7); const v4f l8 = GDN_L4(48, 8); const v4f l9 = GDN_L4(48, 9); const v4f l10 = GDN_L4(48, 10); const v4f l11 = GDN_L4(48, 11); __builtin_amdgcn_sched_barrier(0); x48 -= l6.x * x24; x48 -= l6.y * x25; x48 -= l6.z * x26; x48 -= l6.w * x27; x48 -= l7.x * x28; x48 -= l7.y * x29; x48 -= l7.z * x30; x48 -= l7.w * x31; x48 -= l8.x * x32; x48 -= l8.y * x33; x48 -= l8.z * x34; x48 -= l8.w * x35; x48 -= l9.x * x36; x48 -= l9.y * x37; x48 -= l9.z * x38; x48 -= l9.w * x39; x48 -= l10.x * x40; x48 -= l10.y * x41; x48 -= l10.z * x42; x48 -= l10.w * x43; x48 -= l11.x * x44; x48 -= l11.y * x45; x48 -= l11.z * x46; x48 -= l11.w * x47; } __builtin_amdgcn_sched_barrier(0);
        float x49 = GDN_RHS(49); { const v4f l0 = GDN_L4(49, 0); const v4f l1 = GDN_L4(49, 1); const v4f l2 = GDN_L4(49, 2); const v4f l3 = GDN_L4(49, 3); const v4f l4 = GDN_L4(49, 4); const v4f l5 = GDN_L4(49, 5); __builtin_amdgcn_sched_barrier(0); x49 -= l0.x * x0; x49 -= l0.y * x1; x49 -= l0.z * x2; x49 -= l0.w * x3; x49 -= l1.x * x4; x49 -= l1.y * x5; x49 -= l1.z * x6; x49 -= l1.w * x7; x49 -= l2.x * x8; x49 -= l2.y * x9; x49 -= l2.z * x10; x49 -= l2.w * x11; x49 -= l3.x * x12; x49 -= l3.y * x13; x49 -= l3.z * x14; x49 -= l3.w * x15; x49 -= l4.x * x16; x49 -= l4.y * x17; x49 -= l4.z * x18; x49 -= l4.w * x19; x49 -= l5.x * x20; x49 -= l5.y * x21; x49 -= l5.z * x22; x49 -= l5.w * x23; } __builtin_amdgcn_sched_barrier(0); { const v4f l6 = GDN_L4(49, 6); const v4f l7 = GDN_L4(49, 7); const v4f l8 = GDN_L4(49, 8); const v4f l9 = GDN_L4(49, 9); const v4f l10 = GDN_L4(49, 10); const v4f l11 = GDN_L4(49, 11); __builtin_amdgcn_sched_barrier(0); x49 -= l6.x * x24; x49 -= l6.y * x25; x49 -= l6.z * x26; x49 -= l6.w * x27; x49 -= l7.x * x28; x49 -= l7.y * x29; x49 -= l7.z * x30; x49 -= l7.w * x31; x49 -= l8.x * x32; x49 -= l8.y * x33; x49 -= l8.z * x34; x49 -= l8.w * x35; x49 -= l9.x * x36; x49 -= l9.y * x37; x49 -= l9.z * x38; x49 -= l9.w * x39; x49 -= l10.x * x40; x49 -= l10.y * x41; x49 -= l10.z * x42; x49 -= l10.w * x43; x49 -= l11.x * x44; x49 -= l11.y * x45; x49 -= l11.z * x46; x49 -= l11.w * x47; } __builtin_amdgcn_sched_barrier(0); { const v4f l12 = GDN_L4(49, 12); __builtin_amdgcn_sched_barrier(0); x49 -= l12.x * x48; } __builtin_amdgcn_sched_barrier(0);
        float x50 = GDN_RHS(50); { const v4f l0 = GDN_L4(50, 0); const v4f l1 = GDN_L4(50, 1); const v4f l2 = GDN_L4(50, 2); const v4f l3 = GDN_L4(50, 3); const v4f l4 = GDN_L4(50, 4); const v4f l5 = GDN_L4(50, 5); __builtin_amdgcn_sched_barrier(0); x50 -= l0.x * x0; x50 -= l0.y * x1; x50 -= l0.z * x2; x50 -= l0.w * x3; x50 -= l1.x * x4; x50 -= l1.y * x5; x50 -= l1.z * x6; x50 -= l1.w * x7; x50 -= l2.x * x8; x50 -= l2.y * x9; x50 -= l2.z * x10; x50 -= l2.w * x11; x50 -= l3.x * x12; x50 -= l3.y * x13; x50 -= l3.z * x14; x50 -= l3.w * x15; x50 -= l4.x * x16; x50 -= l4.y * x17; x50 -= l4.z * x18; x50 -= l4.w * x19; x50 -= l5.x * x20; x50 -= l5.y * x21; x50 -= l5.z * x22; x50 -= l5.w * x23; } __builtin_amdgcn_sched_barrier(0); { const v4f l6 = GDN_L4(50, 6); const v4f l7 = GDN_L4(50, 7); const v4f l8 = GDN_L4(50, 8); const v4f l9 = GDN_L4(50, 9); const v4f l10 = GDN_L4(50, 10); const v4f l11 = GDN_L4(50, 11); __builtin_amdgcn_sched_barrier(0); x50 -= l6.x * x24; x50 -= l6.y * x25; x50 -= l6.z * x26; x50 -= l6.w * x27; x50 -= l7.x * x28; x50 -= l7.y * x29; x50 -= l7.z * x30; x50 -= l7.w * x31; x50 -= l8.x * x32; x50 -= l8.y * x33; x50 -= l8.z * x34; x50 -= l8.w * x35; x50 -= l9.x * x36; x50 -= l9.y * x37; x50 -= l9.z * x38; x50 -= l9.w * x39; x50 -= l10.x * x40; x50 -= l10.y * x41; x50 -= l10.z * x42; x50 -= l10.w * x43; x50 -= l11.x * x44; x50 -= l11.y * x45; x50 -= l11.z * x46; x50 -= l11.w * x47; } __builtin_amdgcn_sched_barrier(0); { const v4f l12 = GDN_L4(50, 12); __builtin_amdgcn_sched_barrier(0); x50 -= l12.x * x48; x50 -= l12.y * x49; } __builtin_amdgcn_sched_barrier(0);
        float x51 = GDN_RHS(51); { const v4f l0 = GDN_L4(51, 0); const v4f l1 = GDN_L4(51, 1); const v4f l2 = GDN_L4(51, 2); const v4f l3 = GDN_L4(51, 3); const v4f l4 = GDN_L4(51, 4); const v4f l5 = GDN_L4(51, 5); __builtin_amdgcn_sched_barrier(0); x51 -= l0.x * x0; x51 -= l0.y * x1; x51 -= l0.z * x2; x51 -= l0.w * x3; x51 -= l1.x * x4; x51 -= l1.y * x5; x51 -= l1.z * x6; x51 -= l1.w * x7; x51 -= l2.x * x8; x51 -= l2.y * x9; x51 -= l2.z * x10; x51 -= l2.w * x11; x51 -= l3.x * x12; x51 -= l3.y * x13; x51 -= l3.z * x14; x51 -= l3.w * x15; x51 -= l4.x * x16; x51 -= l4.y * x17; x51 -= l4.z * x18; x51 -= l4.w * x19; x51 -= l5.x * x20; x51 -= l5.y * x21; x51 -= l5.z * x22; x51 -= l5.w * x23; } __builtin_amdgcn_sched_barrier(0); { const v4f l6 = GDN_L4(51, 6); const v4f l7 = GDN_L4(51, 7); const v4f l8 = GDN_L4(51, 8); const v4f l9 = GDN_L4(51, 9); const v4f l10 = GDN_L4(51, 10); const v4f l11 = GDN_L4(51, 11); __builtin_amdgcn_sched_barrier(0); x51 -= l6.x * x24; x51 -= l6.y * x25; x51 -= l6.z * x26; x51 -= l6.w * x27; x51 -= l7.x * x28; x51 -= l7.y * x29; x51 -= l7.z * x30; x51 -= l7.w * x31; x51 -= l8.x * x32; x51 -= l8.y * x33; x51 -= l8.z * x34; x51 -= l8.w * x35; x51 -= l9.x * x36; x51 -= l9.y * x37; x51 -= l9.z * x38; x51 -= l9.w * x39; x51 -= l10.x * x40; x51 -= l10.y * x41; x51 -= l10.z * x42; x51 -= l10.w * x43; x51 -= l11.x * x44; x51 -= l11.y * x45; x51 -= l11.z * x46; x51 -= l11.w * x47; } __builtin_amdgcn_sched_barrier(0); { const v4f l12 = GDN_L4(51, 12); __builtin_amdgcn_sched_barrier(0); x51 -= l12.x * x48; x51 -= l12.y * x49; x51 -= l12.z * x50; } __builtin_amdgcn_sched_barrier(0);
        float x52 = GDN_RHS(52); { const v4f l0 = GDN_L4(52, 0); const v4f l1 = GDN_L4(52, 1); const v4f l2 = GDN_L4(52, 2); const v4f l3 = GDN_L4(52, 3); const v4f l4 = GDN_L4(52, 4); const v4f l5 = GDN_L4(52, 5); __builtin_amdgcn_sched_barrier(0); x52 -= l0.x * x0; x52 -= l0.y * x1; x52 -= l0.z * x2; x52 -= l0.w * x3; x52 -= l1.x * x4; x52 -= l1.y * x5; x52 -= l1.z * x6; x52 -= l1.w * x7; x52 -= l2.x * x8; x52 -= l2.y * x9; x52 -= l2.z * x10; x52 -= l2.w * x11; x52 -= l3.x * x12; x52 -= l3.y * x13; x52 -= l3.z * x14; x52 -= l3.w * x15; x52 -= l4.x * x16; x52 -= l4.y * x17; x52 -= l4.z * x18; x52 -= l4.w * x19; x52 -= l5.x * x20; x52 -= l5.y * x21; x52 -= l5.z * x22; x52 -= l5.w * x23; } __builtin_amdgcn_sched_barrier(0); { const v4f l6 = GDN_L4(52, 6); const v4f l7 = GDN_L4(52, 7); const v4f l8 = GDN_L4(52, 8); const v4f l9 = GDN_L4(52, 9); const v4f l10 = GDN_L4(52, 10); const v4f l11 = GDN_L4(52, 11); __builtin_amdgcn_sched_barrier(0); x52 -= l6.x * x24; x52 -= l6.y * x25; x52 -= l6.z * x26; x52 -= l6.w * x27; x52 -= l7.x * x28; x52 -= l7.y * x29; x52 -= l7.z * x30; x52 -= l7.w * x31; x52 -= l8.x * x32; x52 -= l8.y * x33; x52 -= l8.z * x34; x52 -= l8.w * x35; x52 -= l9.x * x36; x52 -= l9.y * x37; x52 -= l9.z * x38; x52 -= l9.w * x39; x52 -= l10.x * x40; x52 -= l10.y * x41; x52 -= l10.z * x42; x52 -= l10.w * x43; x52 -= l11.x * x44; x52 -= l11.y * x45; x52 -= l11.z * x46; x52 -= l11.w * x47; } __builtin_amdgcn_sched_barrier(0); { const v4f l12 = GDN_L4(52, 12); __builtin_amdgcn_sched_barrier(0); x52 -= l12.x * x48; x52 -= l12.y * x49; x52 -= l12.z * x50; x52 -= l12.w * x51; } __builtin_amdgcn_sched_barrier(0);
        float x53 = GDN_RHS(53); { const v4f l0 = GDN_L4(53, 0); const v4f l1 = GDN_L4(53, 1); const v4f l2 = GDN_L4(53, 2); const v4f l3 = GDN_L4(53, 3); const v4f l4 = GDN_L4(53, 4); const v4f l5 = GDN_L4(53, 5); __builtin_amdgcn_sched_barrier(0); x53 -= l0.x * x0; x53 -= l0.y * x1; x53 -= l0.z * x2; x53 -= l0.w * x3; x53 -= l1.x * x4; x53 -= l1.y * x5; x53 -= l1.z * x6; x53 -= l1.w * x7; x53 -= l2.x * x8; x53 -= l2.y * x9; x53 -= l2.z * x10; x53 -= l2.w * x11; x53 -= l3.x * x12; x53 -= l3.y * x13; x53 -= l3.z * x14; x53 -= l3.w * x15; x53 -= l4.x * x16; x53 -= l4.y * x17; x53 -= l4.z * x18; x53 -= l4.w * x19; x53 -= l5.x * x20; x53 -= l5.y * x21; x53 -= l5.z * x22; x53 -= l5.w * x23; } __builtin_amdgcn_sched_barrier(0); { const v4f l6 = GDN_L4(53, 6); const v4f l7 = GDN_L4(53, 7); const v4f l8 = GDN_L4(53, 8); const v4f l9 = GDN_L4(53, 9); const v4f l10 = GDN_L4(53, 10); const v4f l11 = GDN_L4(53, 11); __builtin_amdgcn_sched_barrier(0); x53 -= l6.x * x24; x53 -= l6.y * x25; x53 -= l6.z * x26; x53 -= l6.w * x27; x53 -= l7.x * x28; x53 -= l7.y * x29; x53 -= l7.z * x30; x53 -= l7.w * x31; x53 -= l8.x * x32; x53 -= l8.y * x33; x53 -= l8.z * x34; x53 -= l8.w * x35; x53 -= l9.x * x36; x53 -= l9.y * x37; x53 -= l9.z * x38; x53 -= l9.w * x39; x53 -= l10.x * x40; x53 -= l10.y * x41; x53 -= l10.z * x42; x53 -= l10.w * x43; x53 -= l11.x * x44; x53 -= l11.y * x45; x53 -= l11.z * x46; x53 -= l11.w * x47; } __builtin_amdgcn_sched_barrier(0); { const v4f l12 = GDN_L4(53, 12); const v4f l13 = GDN_L4(53, 13); __builtin_amdgcn_sched_barrier(0); x53 -= l12.x * x48; x53 -= l12.y * x49; x53 -= l12.z * x50; x53 -= l12.w * x51; x53 -= l13.x * x52; } __builtin_amdgcn_sched_barrier(0);
        float x54 = GDN_RHS(54); { const v4f l0 = GDN_L4(54, 0); const v4f l1 = GDN_L4(54, 1); const v4f l2 = GDN_L4(54, 2); const v4f l3 = GDN_L4(54, 3); const v4f l4 = GDN_L4(54, 4); const v4f l5 = GDN_L4(54, 5); __builtin_amdgcn_sched_barrier(0); x54 -= l0.x * x0; x54 -= l0.y * x1; x54 -= l0.z * x2; x54 -= l0.w * x3; x54 -= l1.x * x4; x54 -= l1.y * x5; x54 -= l1.z * x6; x54 -= l1.w * x7; x54 -= l2.x * x8; x54 -= l2.y * x9; x54 -= l2.z * x10; x54 -= l2.w * x11; x54 -= l3.x * x12; x54 -= l3.y * x13; x54 -= l3.z * x14; x54 -= l3.w * x15; x54 -= l4.x * x16; x54 -= l4.y * x17; x54 -= l4.z * x18; x54 -= l4.w * x19; x54 -= l5.x * x20; x54 -= l5.y * x21; x54 -= l5.z * x22; x54 -= l5.w * x23; } __builtin_amdgcn_sched_barrier(0); { const v4f l6 = GDN_L4(54, 6); const v4f l7 = GDN_L4(54, 7); const v4f l8 = GDN_L4(54, 8); const v4f l9 = GDN_L4(54, 9); const v4f l10 = GDN_L4(54, 10); const v4f l11 = GDN_L4(54, 11); __builtin_amdgcn_sched_barrier(0); x54 -= l6.x * x24; x54 -= l6.y * x25; x54 -= l6.z * x26; x54 -= l6.w * x27; x54 -= l7.x * x28; x54 -= l7.y * x29; x54 -= l7.z * x30; x54 -= l7.w * x31; x54 -= l8.x * x32; x54 -= l8.y * x33; x54 -= l8.z * x34; x54 -= l8.w * x35; x54 -= l9.x * x36; x54 -= l9.y * x37; x54 -= l9.z * x38; x54 -= l9.w * x39; x54 -= l10.x * x40; x54 -= l10.y * x41; x54 -= l10.z * x42; x54 -= l10.w * x43; x54 -= l11.x * x44; x54 -= l11.y * x45; x54 -= l11.z * x46; x54 -= l11.w * x47; } __builtin_amdgcn_sched_barrier(0); { const v4f l12 = GDN_L4(54, 12); const v4f l13 = GDN_L4(54, 13); __builtin_amdgcn_sched_barrier(0); x54 -= l12.x * x48; x54 -= l12.y * x49; x54 -= l12.z * x50; x54 -= l12.w * x51; x54 -= l13.x * x52; x54 -= l13.y * x53; } __builtin_amdgcn_sched_barrier(0);
        float x55 = GDN_RHS(55); { const v4f l0 = GDN_L4(55, 0); const v4f l1 = GDN_L4(55, 1); const v4f l2 = GDN_L4(55, 2); const v4f l3 = GDN_L4(55, 3); const v4f l4 = GDN_L4(55, 4); const v4f l5 = GDN_L4(55, 5); __builtin_amdgcn_sched_barrier(0); x55 -= l0.x * x0; x55 -= l0.y * x1; x55 -= l0.z * x2; x55 -= l0.w * x3; x55 -= l1.x * x4; x55 -= l1.y * x5; x55 -= l1.z * x6; x55 -= l1.w * x7; x55 -= l2.x * x8; x55 -= l2.y * x9; x55 -= l2.z * x10; x55 -= l2.w * x11; x55 -= l3.x * x12; x55 -= l3.y * x13; x55 -= l3.z * x14; x55 -= l3.w * x15; x55 -= l4.x * x16; x55 -= l4.y * x17; x55 -= l4.z * x18; x55 -= l4.w * x19; x55 -= l5.x * x20; x55 -= l5.y * x21; x55 -= l5.z * x22; x55 -= l5.w * x23; } __builtin_amdgcn_sched_barrier(0); { const v4f l6 = GDN_L4(55, 6); const v4f l7 = GDN_L4(55, 7); const v4f l8 = GDN_L4(55, 8); const v4f l9 = GDN_L4(55, 9); const v4f l10 = GDN_L4(55, 10); const v4f l11 = GDN_L4(55, 11); __builtin_amdgcn_sched_barrier(0); x55 -= l6.x * x24; x55 -= l6.y * x25; x55 -= l6.z * x26; x55 -= l6.w * x27; x55 -= l7.x * x28; x55 -= l7.y * x29; x55 -= l7.z * x30; x55 -= l7.w * x31; x55 -= l8.x * x32; x55 -= l8.y * x33; x55 -= l8.z * x34; x55 -= l8.w * x35; x55 -= l9.x * x36; x55 -= l9.y * x37; x55 -= l9.z * x38; x55 -= l9.w * x39; x55 -= l10.x * x40; x55 -= l10.y * x41; x55 -= l10.z * x42; x55 -= l10.w * x43; x55 -= l11.x * x44; x55 -= l11.y * x45; x55 -= l11.z * x46; x55 -= l11.w * x47; } __builtin_amdgcn_sched_barrier(0); { const v4f l12 = GDN_L4(55, 12); const v4f l13 = GDN_L4(55, 13); __builtin_amdgcn_sched_barrier(0); x55 -= l12.x * x48; x55 -= l12.y * x49; x55 -= l12.z * x50; x55 -= l12.w * x51; x55 -= l13.x * x52; x55 -= l13.y * x53; x55 -= l13.z * x54; } __builtin_amdgcn_sched_barrier(0);
        float x56 = GDN_RHS(56); { const v4f l0 = GDN_L4(56, 0); const v4f l1 = GDN_L4(56, 1); const v4f l2 = GDN_L4(56, 2); const v4f l3 = GDN_L4(56, 3); const v4f l4 = GDN_L4(56, 4); const v4f l5 = GDN_L4(56, 5); __builtin_amdgcn_sched_barrier(0); x56 -= l0.x * x0; x56 -= l0.y * x1; x56 -= l0.z * x2; x56 -= l0.w * x3; x56 -= l1.x * x4; x56 -= l1.y * x5; x56 -= l1.z * x6; x56 -= l1.w * x7; x56 -= l2.x * x8; x56 -= l2.y * x9; x56 -= l2.z * x10; x56 -= l2.w * x11; x56 -= l3.x * x12; x56 -= l3.y * x13; x56 -= l3.z * x14; x56 -= l3.w * x15; x56 -= l4.x * x16; x56 -= l4.y * x17; x56 -= l4.z * x18; x56 -= l4.w * x19; x56 -= l5.x * x20; x56 -= l5.y * x21; x56 -= l5.z * x22; x56 -= l5.w * x23; } __builtin_amdgcn_sched_barrier(0); { const v4f l6 = GDN_L4(56, 6); const v4f l7 = GDN_L4(56, 7); const v4f l8 = GDN_L4(56, 8); const v4f l9 = GDN_L4(56, 9); const v4f l10 = GDN_L4(56, 10); const v4f l11 = GDN_L4(56, 11); __builtin_amdgcn_sched_barrier(0); x56 -= l6.x * x24; x56 -= l6.y * x25; x56 -= l6.z * x26; x56 -= l6.w * x27; x56 -= l7.x * x28; x56 -= l7.y * x29; x56 -= l7.z * x30; x56 -= l7.w * x31; x56 -= l8.x * x32; x56 -= l8.y * x33; x56 -= l8.z * x34; x56 -= l8.w * x35; x56 -= l9.x * x36; x56 -= l9.y * x37; x56 -= l9.z * x38; x56 -= l9.w * x39; x56 -= l10.x * x40; x56 -= l10.y * x41; x56 -= l10.z * x42; x56 -= l10.w * x43; x56 -= l11.x * x44; x56 -= l11.y * x45; x56 -= l11.z * x46; x56 -= l11.w * x47; } __builtin_amdgcn_sched_barrier(0); { const v4f l12 = GDN_L4(56, 12); const v4f l13 = GDN_L4(56, 13); __builtin_amdgcn_sched_barrier(0); x56 -= l12.x * x48; x56 -= l12.y * x49; x56 -= l12.z * x50; x56 -= l12.w * x51; x56 -= l13.x * x52; x56 -= l13.y * x53; x56 -= l13.z * x54; x56 -= l13.w * x55; } __builtin_amdgcn_sched_barrier(0);
        float x57 = GDN_RHS(57); { const v4f l0 = GDN_L4(57, 0); const v4f l1 = GDN_L4(57, 1); const v4f l2 = GDN_L4(57, 2); const v4f l3 = GDN_L4(57, 3); const v4f l4 = GDN_L4(57, 4); const v4f l5 = GDN_L4(57, 5); __builtin_amdgcn_sched_barrier(0); x57 -= l0.x * x0; x57 -= l0.y * x1; x57 -= l0.z * x2; x57 -= l0.w * x3; x57 -= l1.x * x4; x57 -= l1.y * x5; x57 -= l1.z * x6; x57 -= l1.w * x7; x57 -= l2.x * x8; x57 -= l2.y * x9; x57 -= l2.z * x10; x57 -= l2.w * x11; x57 -= l3.x * x12; x57 -= l3.y * x13; x57 -= l3.z * x14; x57 -= l3.w * x15; x57 -= l4.x * x16; x57 -= l4.y * x17; x57 -= l4.z * x18; x57 -= l4.w * x19; x57 -= l5.x * x20; x57 -= l5.y * x21; x57 -= l5.z * x22; x57 -= l5.w * x23; } __builtin_amdgcn_sched_barrier(0); { const v4f l6 = GDN_L4(57, 6); const v4f l7 = GDN_L4(57, 7); const v4f l8 = GDN_L4(57, 8); const v4f l9 = GDN_L4(57, 9); const v4f l10 = GDN_L4(57, 10); const v4f l11 = GDN_L4(57, 11); __builtin_amdgcn_sched_barrier(0); x57 -= l6.x * x24; x57 -= l6.y * x25; x57 -= l6.z * x26; x57 -= l6.w * x27; x57 -= l7.x * x28; x57 -= l7.y * x29; x57 -= l7.z * x30; x57 -= l7.w * x31; x57 -= l8.x * x32; x57 -= l8.y * x33; x57 -= l8.z * x34; x57 -= l8.w * x35; x57 -= l9.x * x36; x57 -= l9.y * x37; x57 -= l9.z * x38; x57 -= l9.w * x39; x57 -= l10.x * x40; x57 -= l10.y * x41; x57 -= l10.z * x42; x57 -= l10.w * x43; x57 -= l11.x * x44; x57 -= l11.y * x45; x57 -= l11.z * x46; x57 -= l11.w * x47; } __builtin_amdgcn_sched_barrier(0); { const v4f l12 = GDN_L4(57, 12); const v4f l13 = GDN_L4(57, 13); const v4f l14 = GDN_L4(57, 14); __builtin_amdgcn_sched_barrier(0); x57 -= l12.x * x48; x57 -= l12.y * x49; x57 -= l12.z * x50; x57 -= l12.w * x51; x57 -= l13.x * x52; x57 -= l13.y * x53; x57 -= l13.z * x54; x57 -= l13.w * x55; x57 -= l14.x * x56; } __builtin_amdgcn_sched_barrier(0);
        float x58 = GDN_RHS(58); { const v4f l0 = GDN_L4(58, 0); const v4f l1 = GDN_L4(58, 1); const v4f l2 = GDN_L4(58, 2); const v4f l3 = GDN_L4(58, 3); const v4f l4 = GDN_L4(58, 4); const v4f l5 = GDN_L4(58, 5); __builtin_amdgcn_sched_barrier(0); x58 -= l0.x * x0; x58 -= l0.y * x1; x58 -= l0.z * x2; x58 -= l0.w * x3; x58 -= l1.x * x4; x58 -= l1.y * x5; x58 -= l1.z * x6; x58 -= l1.w * x7; x58 -= l2.x * x8; x58 -= l2.y * x9; x58 -= l2.z * x10; x58 -= l2.w * x11; x58 -= l3.x * x12; x58 -= l3.y * x13; x58 -= l3.z * x14; x58 -= l3.w * x15; x58 -= l4.x * x16; x58 -= l4.y * x17; x58 -= l4.z * x18; x58 -= l4.w * x19; x58 -= l5.x * x20; x58 -= l5.y * x21; x58 -= l5.z * x22; x58 -= l5.w * x23; } __builtin_amdgcn_sched_barrier(0); { const v4f l6 = GDN_L4(58, 6); const v4f l7 = GDN_L4(58, 7); const v4f l8 = GDN_L4(58, 8); const v4f l9 = GDN_L4(58, 9); const v4f l10 = GDN_L4(58, 10); const v4f l11 = GDN_L4(58, 11); __builtin_amdgcn_sched_barrier(0); x58 -= l6.x * x24; x58 -= l6.y * x25; x58 -= l6.z * x26; x58 -= l6.w * x27; x58 -= l7.x * x28; x58 -= l7.y * x29; x58 -= l7.z * x30; x58 -= l7.w * x31; x58 -= l8.x * x32; x58 -= l8.y * x33; x58 -= l8.z * x34; x58 -= l8.w * x35; x58 -= l9.x * x36; x58 -= l9.y * x37; x58 -= l9.z * x38; x58 -= l9.w * x39; x58 -= l10.x * x40; x58 -= l10.y * x41; x58 -= l10.z * x42; x58 -= l10.w * x43; x58 -= l11.x * x44; x58 -= l11.y * x45; x58 -= l11.z * x46; x58 -= l11.w * x47; } __builtin_amdgcn_sched_barrier(0); { const v4f l12 = GDN_L4(58, 12); const v4f l13 = GDN_L4(58, 13); const v4f l14 = GDN_L4(58, 14); __builtin_amdgcn_sched_barrier(0); x58 -= l12.x * x48; x58 -= l12.y * x49; x58 -= l12.z * x50; x58 -= l12.w * x51; x58 -= l13.x * x52; x58 -= l13.y * x53; x58 -= l13.z * x54; x58 -= l13.w * x55; x58 -= l14.x * x56; x58 -= l14.y * x57; } __builtin_amdgcn_sched_barrier(0);
        float x59 = GDN_RHS(59); { const v4f l0 = GDN_L4(59, 0); const v4f l1 = GDN_L4(59, 1); const v4f l2 = GDN_L4(59, 2); const v4f l3 = GDN_L4(59, 3); const v4f l4 = GDN_L4(59, 4); const v4f l5 = GDN_L4(59, 5); __builtin_amdgcn_sched_barrier(0); x59 -= l0.x * x0; x59 -= l0.y * x1; x59 -= l0.z * x2; x59 -= l0.w * x3; x59 -= l1.x * x4; x59 -= l1.y * x5; x59 -= l1.z * x6; x59 -= l1.w * x7; x59 -= l2.x * x8; x59 -= l2.y * x9; x59 -= l2.z * x10; x59 -= l2.w * x11; x59 -= l3.x * x12; x59 -= l3.y * x13; x59 -= l3.z * x14; x59 -= l3.w * x15; x59 -= l4.x * x16; x59 -= l4.y * x17; x59 -= l4.z * x18; x59 -= l4.w * x19; x59 -= l5.x * x20; x59 -= l5.y * x21; x59 -= l5.z * x22; x59 -= l5.w * x23; } __builtin_amdgcn_sched_barrier(0); { const v4f l6 = GDN_L4(59, 6); const v4f l7 = GDN_L4(59, 7); const v4f l8 = GDN_L4(59, 8); const v4f l9 = GDN_L4(59, 9); const v4f l10 = GDN_L4(59, 10); const v4f l11 = GDN_L4(59, 11); __builtin_amdgcn_sched_barrier(0); x59 -= l6.x * x24; x59 -= l6.y * x25; x59 -= l6.z * x26; x59 -= l6.w * x27; x59 -= l7.x * x28; x59 -= l7.y * x29; x59 -= l7.z * x30; x59 -= l7.w * x31; x59 -= l8.x * x32; x59 -= l8.y * x33; x59 -= l8.z * x34; x59 -= l8.w * x35; x59 -= l9.x * x36; x59 -= l9.y * x37; x59 -= l9.z * x38; x59 -= l9.w * x39; x59 -= l10.x * x40; x59 -= l10.y * x41; x59 -= l10.z * x42; x59 -= l10.w * x43; x59 -= l11.x * x44; x59 -= l11.y * x45; x59 -= l11.z * x46; x59 -= l11.w * x47; } __builtin_amdgcn_sched_barrier(0); { const v4f l12 = GDN_L4(59, 12); const v4f l13 = GDN_L4(59, 13); const v4f l14 = GDN_L4(59, 14); __builtin_amdgcn_sched_barrier(0); x59 -= l12.x * x48; x59 -= l12.y * x49; x59 -= l12.z * x50; x59 -= l12.w * x51; x59 -= l13.x * x52; x59 -= l13.y * x53; x59 -= l13.z * x54; x59 -= l13.w * x55; x59 -= l14.x * x56; x59 -= l14.y * x57; x59 -= l14.z * x58; } __builtin_amdgcn_sched_barrier(0);
        float x60 = GDN_RHS(60); { const v4f l0 = GDN_L4(60, 0); const v4f l1 = GDN_L4(60, 1); const v4f l2 = GDN_L4(60, 2); const v4f l3 = GDN_L4(60, 3); const v4f l4 = GDN_L4(60, 4); const v4f l5 = GDN_L4(60, 5); __builtin_amdgcn_sched_barrier(0); x60 -= l0.x * x0; x60 -= l0.y * x1; x60 -= l0.z * x2; x60 -= l0.w * x3; x60 -= l1.x * x4; x60 -= l1.y * x5; x60 -= l1.z * x6; x60 -= l1.w * x7; x60 -= l2.x * x8; x60 -= l2.y * x9; x60 -= l2.z * x10; x60 -= l2.w * x11; x60 -= l3.x * x12; x60 -= l3.y * x13; x60 -= l3.z * x14; x60 -= l3.w * x15; x60 -= l4.x * x16; x60 -= l4.y * x17; x60 -= l4.z * x18; x60 -= l4.w * x19; x60 -= l5.x * x20; x60 -= l5.y * x21; x60 -= l5.z * x22; x60 -= l5.w * x23; } __builtin_amdgcn_sched_barrier(0); { const v4f l6 = GDN_L4(60, 6); const v4f l7 = GDN_L4(60, 7); const v4f l8 = GDN_L4(60, 8); const v4f l9 = GDN_L4(60, 9); const v4f l10 = GDN_L4(60, 10); const v4f l11 = GDN_L4(60, 11); __builtin_amdgcn_sched_barrier(0); x60 -= l6.x * x24; x60 -= l6.y * x25; x60 -= l6.z * x26; x60 -= l6.w * x27; x60 -= l7.x * x28; x60 -= l7.y * x29; x60 -= l7.z * x30; x60 -= l7.w * x31; x60 -= l8.x * x32; x60 -= l8.y * x33; x60 -= l8.z * x34; x60 -= l8.w * x35; x60 -= l9.x * x36; x60 -= l9.y * x37; x60 -= l9.z * x38; x60 -= l9.w * x39; x60 -= l10.x * x40; x60 -= l10.y * x41; x60 -= l10.z * x42; x60 -= l10.w * x43; x60 -= l11.x * x44; x60 -= l11.y * x45; x60 -= l11.z * x46; x60 -= l11.w * x47; } __builtin_amdgcn_sched_barrier(0); { const v4f l12 = GDN_L4(60, 12); const v4f l13 = GDN_L4(60, 13); const v4f l14 = GDN_L4(60, 14); __builtin_amdgcn_sched_barrier(0); x60 -= l12.x * x48; x60 -= l12.y * x49; x60 -= l12.z * x50; x60 -= l12.w * x51; x60 -= l13.x * x52; x60 -= l13.y * x53; x60 -= l13.z * x54; x60 -= l13.w * x55; x60 -= l14.x * x56; x60 -= l14.y * x57; x60 -= l14.z * x58; x60 -= l14.w * x59; } __builtin_amdgcn_sched_barrier(0);
        float x61 = GDN_RHS(61); { const v4f l0 = GDN_L4(61, 0); const v4f l1 = GDN_L4(61, 1); const v4f l2 = GDN_L4(61, 2); const v4f l3 = GDN_L4(61, 3); const v4f l4 = GDN_L4(61, 4); const v4f l5 = GDN_L4(61, 5); __builtin_amdgcn_sched_barrier(0); x61 -= l0.x * x0; x61 -= l0.y * x1; x61 -= l0.z * x2; x61 -= l0.w * x3; x61 -= l1.x * x4; x61 -= l1.y * x5; x61 -= l1.z * x6; x61 -= l1.w * x7; x61 -= l2.x * x8; x61 -= l2.y * x9; x61 -= l2.z * x10; x61 -= l2.w * x11; x61 -= l3.x * x12; x61 -= l3.y * x13; x61 -= l3.z * x14; x61 -= l3.w * x15; x61 -= l4.x * x16; x61 -= l4.y * x17; x61 -= l4.z * x18; x61 -= l4.w * x19; x61 -= l5.x * x20; x61 -= l5.y * x21; x61 -= l5.z * x22; x61 -= l5.w * x23; } __builtin_amdgcn_sched_barrier(0); { const v4f l6 = GDN_L4(61, 6); const v4f l7 = GDN_L4(61, 7); const v4f l8 = GDN_L4(61, 8); const v4f l9 = GDN_L4(61, 9); const v4f l10 = GDN_L4(61, 10); const v4f l11 = GDN_L4(61, 11); __builtin_amdgcn_sched_barrier(0); x61 -= l6.x * x24; x61 -= l6.y * x25; x61 -= l6.z * x26; x61 -= l6.w * x27; x61 -= l7.x * x28; x61 -= l7.y * x29; x61 -= l7.z * x30; x61 -= l7.w * x31; x61 -= l8.x * x32; x61 -= l8.y * x33; x61 -= l8.z * x34; x61 -= l8.w * x35; x61 -= l9.x * x36; x61 -= l9.y * x37; x61 -= l9.z * x38; x61 -= l9.w * x39; x61 -= l10.x * x40; x61 -= l10.y * x41; x61 -= l10.z * x42; x61 -= l10.w * x43; x61 -= l11.x * x44; x61 -= l11.y * x45; x61 -= l11.z * x46; x61 -= l11.w * x47; } __builtin_amdgcn_sched_barrier(0); { const v4f l12 = GDN_L4(61, 12); const v4f l13 = GDN_L4(61, 13); const v4f l14 = GDN_L4(61, 14); const v4f l15 = GDN_L4(61, 15); __builtin_amdgcn_sched_barrier(0); x61 -= l12.x * x48; x61 -= l12.y * x49; x61 -= l12.z * x50; x61 -= l12.w * x51; x61 -= l13.x * x52; x61 -= l13.y * x53; x61 -= l13.z * x54; x61 -= l13.w * x55; x61 -= l14.x * x56; x61 -= l14.y * x57; x61 -= l14.z * x58; x61 -= l14.w * x59; x61 -= l15.x * x60; } __builtin_amdgcn_sched_barrier(0);
        float x62 = GDN_RHS(62); { const v4f l0 = GDN_L4(62, 0); const v4f l1 = GDN_L4(62, 1); const v4f l2 = GDN_L4(62, 2); const v4f l3 = GDN_L4(62, 3); const v4f l4 = GDN_L4(62, 4); const v4f l5 = GDN_L4(62, 5); __builtin_amdgcn_sched_barrier(0); x62 -= l0.x * x0; x62 -= l0.y * x1; x62 -= l0.z * x2; x62 -= l0.w * x3; x62 -= l1.x * x4; x62 -= l1.y * x5; x62 -= l1.z * x6; x62 -= l1.w * x7; x62 -= l2.x * x8; x62 -= l2.y * x9; x62 -= l2.z * x10; x62 -= l2.w * x11; x62 -= l3.x * x12; x62 -= l3.y * x13; x62 -= l3.z * x14; x62 -= l3.w * x15; x62 -= l4.x * x16; x62 -= l4.y * x17; x62 -= l4.z * x18; x62 -= l4.w * x19; x62 -= l5.x * x20; x62 -= l5.y * x21; x62 -= l5.z * x22; x62 -= l5.w * x23; } __builtin_amdgcn_sched_barrier(0); { const v4f l6 = GDN_L4(62, 6); const v4f l7 = GDN_L4(62, 7); const v4f l8 = GDN_L4(62, 8); const v4f l9 = GDN_L4(62, 9); const v4f l10 = GDN_L4(62, 10); const v4f l11 = GDN_L4(62, 11); __builtin_amdgcn_sched_barrier(0); x62 -= l6.x * x24; x62 -= l6.y * x25; x62 -= l6.z * x26; x62 -= l6.w * x27; x62 -= l7.x * x28; x62 -= l7.y * x29; x62 -= l7.z * x30; x62 -= l7.w * x31; x62 -= l8.x * x32; x62 -= l8.y * x33; x62 -= l8.z * x34; x62 -= l8.w * x35; x62 -= l9.x * x36; x62 -= l9.y * x37; x62 -= l9.z * x38; x62 -= l9.w * x39; x62 -= l10.x * x40; x62 -= l10.y * x41; x62 -= l10.z * x42; x62 -= l10.w * x43; x62 -= l11.x * x44; x62 -= l11.y * x45; x62 -= l11.z * x46; x62 -= l11.w * x47; } __builtin_amdgcn_sched_barrier(0); { const v4f l12 = GDN_L4(62, 12); const v4f l13 = GDN_L4(62, 13); const v4f l14 = GDN_L4(62, 14); const v4f l15 = GDN_L4(62, 15); __builtin_amdgcn_sched_barrier(0); x62 -= l12.x * x48; x62 -= l12.y * x49; x62 -= l12.z * x50; x62 -= l12.w * x51; x62 -= l13.x * x52; x62 -= l13.y * x53; x62 -= l13.z * x54; x62 -= l13.w * x55; x62 -= l14.x * x56; x62 -= l14.y * x57; x62 -= l14.z * x58; x62 -= l14.w * x59; x62 -= l15.x * x60; x62 -= l15.y * x61; } __builtin_amdgcn_sched_barrier(0);
        float x63 = GDN_RHS(63); { const v4f l0 = GDN_L4(63, 0); const v4f l1 = GDN_L4(63, 1); const v4f l2 = GDN_L4(63, 2); const v4f l3 = GDN_L4(63, 3); const v4f l4 = GDN_L4(63, 4); const v4f l5 = GDN_L4(63, 5); __builtin_amdgcn_sched_barrier(0); x63 -= l0.x * x0; x63 -= l0.y * x1; x63 -= l0.z * x2; x63 -= l0.w * x3; x63 -= l1.x * x4; x63 -= l1.y * x5; x63 -= l1.z * x6; x63 -= l1.w * x7; x63 -= l2.x * x8; x63 -= l2.y * x9; x63 -= l2.z * x10; x63 -= l2.w * x11; x63 -= l3.x * x12; x63 -= l3.y * x13; x63 -= l3.z * x14; x63 -= l3.w * x15; x63 -= l4.x * x16; x63 -= l4.y * x17; x63 -= l4.z * x18; x63 -= l4.w * x19; x63 -= l5.x * x20; x63 -= l5.y * x21; x63 -= l5.z * x22; x63 -= l5.w * x23; } __builtin_amdgcn_sched_barrier(0); { const v4f l6 = GDN_L4(63, 6); const v4f l7 = GDN_L4(63, 7); const v4f l8 = GDN_L4(63, 8); const v4f l9 = GDN_L4(63, 9); const v4f l10 = GDN_L4(63, 10); const v4f l11 = GDN_L4(63, 11); __builtin_amdgcn_sched_barrier(0); x63 -= l6.x * x24; x63 -= l6.y * x25; x63 -= l6.z * x26; x63 -= l6.w * x27; x63 -= l7.x * x28; x63 -= l7.y * x29; x63 -= l7.z * x30; x63 -= l7.w * x31; x63 -= l8.x * x32; x63 -= l8.y * x33; x63 -= l8.z * x34; x63 -= l8.w * x35; x63 -= l9.x * x36; x63 -= l9.y * x37; x63 -= l9.z * x38; x63 -= l9.w * x39; x63 -= l10.x * x40; x63 -= l10.y * x41; x63 -= l10.z * x42; x63 -= l10.w * x43; x63 -= l11.x * x44; x63 -= l11.y * x45; x63 -= l11.z * x46; x63 -= l11.w * x47; } __builtin_amdgcn_sched_barrier(0); { const v4f l12 = GDN_L4(63, 12); const v4f l13 = GDN_L4(63, 13); const v4f l14 = GDN_L4(63, 14); const v4f l15 = GDN_L4(63, 15); __builtin_amdgcn_sched_barrier(0); x63 -= l12.x * x48; x63 -= l12.y * x49; x63 -= l12.z * x50; x63 -= l12.w * x51; x63 -= l13.x * x52; x63 -= l13.y * x53; x63 -= l13.z * x54; x63 -= l13.w * x55; x63 -= l14.x * x56; x63 -= l14.y * x57; x63 -= l14.z * x58; x63 -= l14.w * x59; x63 -= l15.x * x60; x63 -= l15.y * x61; x63 -= l15.z * x62; } __builtin_amdgcn_sched_barrier(0);
        if (c < 128) { GU[0 * 128 + c] = x0; GU[1 * 128 + c] = x1; GU[2 * 128 + c] = x2; GU[3 * 128 + c] = x3; GU[4 * 128 + c] = x4; GU[5 * 128 + c] = x5; GU[6 * 128 + c] = x6; GU[7 * 128 + c] = x7; GU[8 * 128 + c] = x8; GU[9 * 128 + c] = x9; GU[10 * 128 + c] = x10; GU[11 * 128 + c] = x11; GU[12 * 128 + c] = x12; GU[13 * 128 + c] = x13; GU[14 * 128 + c] = x14; GU[15 * 128 + c] = x15; GU[16 * 128 + c] = x16; GU[17 * 128 + c] = x17; GU[18 * 128 + c] = x18; GU[19 * 128 + c] = x19; GU[20 * 128 + c] = x20; GU[21 * 128 + c] = x21; GU[22 * 128 + c] = x22; GU[23 * 128 + c] = x23; GU[24 * 128 + c] = x24; GU[25 * 128 + c] = x25; GU[26 * 128 + c] = x26; GU[27 * 128 + c] = x27; GU[28 * 128 + c] = x28; GU[29 * 128 + c] = x29; GU[30 * 128 + c] = x30; GU[31 * 128 + c] = x31; GU[32 * 128 + c] = x32; GU[33 * 128 + c] = x33; GU[34 * 128 + c] = x34; GU[35 * 128 + c] = x35; GU[36 * 128 + c] = x36; GU[37 * 128 + c] = x37; GU[38 * 128 + c] = x38; GU[39 * 128 + c] = x39; GU[40 * 128 + c] = x40; GU[41 * 128 + c] = x41; GU[42 * 128 + c] = x42; GU[43 * 128 + c] = x43; GU[44 * 128 + c] = x44; GU[45 * 128 + c] = x45; GU[46 * 128 + c] = x46; GU[47 * 128 + c] = x47; GU[48 * 128 + c] = x48; GU[49 * 128 + c] = x49; GU[50 * 128 + c] = x50; GU[51 * 128 + c] = x51; GU[52 * 128 + c] = x52; GU[53 * 128 + c] = x53; GU[54 * 128 + c] = x54; GU[55 * 128 + c] = x55; GU[56 * 128 + c] = x56; GU[57 * 128 + c] = x57; GU[58 * 128 + c] = x58; GU[59 * 128 + c] = x59; GU[60 * 128 + c] = x60; GU[61 * 128 + c] = x61; GU[62 * 128 + c] = x62; GU[63 * 128 + c] = x63; }
        else { GNW[0 * 128 + (c - 128)] = (bf16)f2bf(-x0); GNW[1 * 128 + (c - 128)] = (bf16)f2bf(-x1); GNW[2 * 128 + (c - 128)] = (bf16)f2bf(-x2); GNW[3 * 128 + (c - 128)] = (bf16)f2bf(-x3); GNW[4 * 128 + (c - 128)] = (bf16)f2bf(-x4); GNW[5 * 128 + (c - 128)] = (bf16)f2bf(-x5); GNW[6 * 128 + (c - 128)] = (bf16)f2bf(-x6); GNW[7 * 128 + (c - 128)] = (bf16)f2bf(-x7); GNW[8 * 128 + (c - 128)] = (bf16)f2bf(-x8); GNW[9 * 128 + (c - 128)] = (bf16)f2bf(-x9); GNW[10 * 128 + (c - 128)] = (bf16)f2bf(-x10); GNW[11 * 128 + (c - 128)] = (bf16)f2bf(-x11); GNW[12 * 128 + (c - 128)] = (bf16)f2bf(-x12); GNW[13 * 128 + (c - 128)] = (bf16)f2bf(-x13); GNW[14 * 128 + (c - 128)] = (bf16)f2bf(-x14); GNW[15 * 128 + (c - 128)] = (bf16)f2bf(-x15); GNW[16 * 128 + (c - 128)] = (bf16)f2bf(-x16); GNW[17 * 128 + (c - 128)] = (bf16)f2bf(-x17); GNW[18 * 128 + (c - 128)] = (bf16)f2bf(-x18); GNW[19 * 128 + (c - 128)] = (bf16)f2bf(-x19); GNW[20 * 128 + (c - 128)] = (bf16)f2bf(-x20); GNW[21 * 128 + (c - 128)] = (bf16)f2bf(-x21); GNW[22 * 128 + (c - 128)] = (bf16)f2bf(-x22); GNW[23 * 128 + (c - 128)] = (bf16)f2bf(-x23); GNW[24 * 128 + (c - 128)] = (bf16)f2bf(-x24); GNW[25 * 128 + (c - 128)] = (bf16)f2bf(-x25); GNW[26 * 128 + (c - 128)] = (bf16)f2bf(-x26); GNW[27 * 128 + (c - 128)] = (bf16)f2bf(-x27); GNW[28 * 128 + (c - 128)] = (bf16)f2bf(-x28); GNW[29 * 128 + (c - 128)] = (bf16)f2bf(-x29); GNW[30 * 128 + (c - 128)] = (bf16)f2bf(-x30); GNW[31 * 128 + (c - 128)] = (bf16)f2bf(-x31); GNW[32 * 128 + (c - 128)] = (bf16)f2bf(-x32); GNW[33 * 128 + (c - 128)] = (bf16)f2bf(-x33); GNW[34 * 128 + (c - 128)] = (bf16)f2bf(-x34); GNW[35 * 128 + (c - 128)] = (bf16)f2bf(-x35); GNW[36 * 128 + (c - 128)] = (bf16)f2bf(-x36); GNW[37 * 128 + (c - 128)] = (bf16)f2bf(-x37); GNW[38 * 128 + (c - 128)] = (bf16)f2bf(-x38); GNW[39 * 128 + (c - 128)] = (bf16)f2bf(-x39); GNW[40 * 128 + (c - 128)] = (bf16)f2bf(-x40); GNW[41 * 128 + (c - 128)] = (bf16)f2bf(-x41); GNW[42 * 128 + (c - 128)] = (bf16)f2bf(-x42); GNW[43 * 128 + (c - 128)] = (bf16)f2bf(-x43); GNW[44 * 128 + (c - 128)] = (bf16)f2bf(-x44); GNW[45 * 128 + (c - 128)] = (bf16)f2bf(-x45); GNW[46 * 128 + (c - 128)] = (bf16)f2bf(-x46); GNW[47 * 128 + (c - 128)] = (bf16)f2bf(-x47); GNW[48 * 128 + (c - 128)] = (bf16)f2bf(-x48); GNW[49 * 128 + (c - 128)] = (bf16)f2bf(-x49); GNW[50 * 128 + (c - 128)] = (bf16)f2bf(-x50); GNW[51 * 128 + (c - 128)] = (bf16)f2bf(-x51); GNW[52 * 128 + (c - 128)] = (bf16)f2bf(-x52); GNW[53 * 128 + (c - 128)] = (bf16)f2bf(-x53); GNW[54 * 128 + (c - 128)] = (bf16)f2bf(-x54); GNW[55 * 128 + (c - 128)] = (bf16)f2bf(-x55); GNW[56 * 128 + (c - 128)] = (bf16)f2bf(-x56); GNW[57 * 128 + (c - 128)] = (bf16)f2bf(-x57); GNW[58 * 128 + (c - 128)] = (bf16)f2bf(-x58); GNW[59 * 128 + (c - 128)] = (bf16)f2bf(-x59); GNW[60 * 128 + (c - 128)] = (bf16)f2bf(-x60); GNW[61 * 128 + (c - 128)] = (bf16)f2bf(-x61); GNW[62 * 128 + (c - 128)] = (bf16)f2bf(-x62); GNW[63 * 128 + (c - 128)] = (bf16)f2bf(-x63); }
#undef GDN_RHS
#undef GDN_L4
    } else {
        const int t2 = tid - 256; const float gl = gcs[63];
        { const int i = t2 >> 2, d0 = (t2 & 3) * 32; const float e = __expf(gcs[i]);
#pragma unroll
          for (int x8 = 0; x8 < 4; ++x8) { const v4f a = *(const LAS v4f*)(qs + i * QP + d0 + 8 * x8), b = *(const LAS v4f*)(qs + i * QP + d0 + 8 * x8 + 4);
              v4u w; w.x = pk2(a.x * e, a.y * e); w.y = pk2(a.z * e, a.w * e); w.z = pk2(b.x * e, b.y * e); w.w = pk2(b.z * e, b.w * e); *(v4u*)(GQG + i * 128 + d0 + 8 * x8) = w; } }
        { const int d = t2 >> 1, j0 = (t2 & 1) * 32;
#pragma unroll
          for (int x8 = 0; x8 < 4; ++x8) { float o[8];
#pragma unroll
              for (int x = 0; x < 8; ++x) { const int j = j0 + 8 * x8 + x; o[x] = ks[j * QP + d] * __expf(gl - gcs[j]); }
              v4u w; w.x = pk2(o[0], o[1]); w.y = pk2(o[2], o[3]); w.z = pk2(o[4], o[5]); w.w = pk2(o[6], o[7]); *(v4u*)(GKT + d * 64 + j0 + 8 * x8) = w; } }
        if (t2 == 0) GDL[item] = __expf(gl);
    }
    __syncthreads();
}
struct GdnFrags { bf16x8_t nw[4], qg[4], at[2], kt[2][2]; float u[4]; float dl; };
__device__ __forceinline__ void gdn_load(GdnFrags& F, const Params& p, int item, int off128, int off64, int offk, int offu) {
    const bf16* GNW = (const bf16*)(p.ws + WS_GNW) + (size_t)item * 8192; const bf16* GQG = (const bf16*)(p.ws + WS_GQG) + (size_t)item * 8192;
    const bf16* GAT = (const bf16*)(p.ws + WS_GAT) + (size_t)item * 4096; const bf16* GKT = (const bf16*)(p.ws + WS_GKT) + (size_t)item * 8192; const float* GU = (const float*)(p.ws + WS_GU) + (size_t)item * 8192;
#pragma unroll
    for (int ks = 0; ks < 4; ++ks) { F.nw[ks] = *(const bf16x8_t*)(GNW + off128 + 32 * ks); F.qg[ks] = *(const bf16x8_t*)(GQG + off128 + 32 * ks); }
#pragma unroll
    for (int ks = 0; ks < 2; ++ks) { F.at[ks] = *(const bf16x8_t*)(GAT + off64 + 32 * ks); F.kt[0][ks] = *(const bf16x8_t*)(GKT + offk + 32 * ks); F.kt[1][ks] = *(const bf16x8_t*)(GKT + offk + 1024 + 32 * ks); }
#pragma unroll
    for (int r = 0; r < 4; ++r) F.u[r] = GU[offu + r * 128];
    F.dl = ((const float*)(p.ws + WS_GDL))[item];
}
constexpr int STP = 136, VNP = 72;
__device__ __forceinline__ void gdn_seq(const Params& p, LAS unsigned char* lds, int wgi, int wave, int lane) {
    const int u = wgi * 2 + (wave >> 2), wi = wave & 3, h = u >> 3, sl = u & 7, g = lane >> 4, c = lane & 15;
    LAS unsigned short* ST = (LAS unsigned short*)(lds + (wave >> 2) * 12288);
    LAS unsigned short* VNT = ST + 2 * 16 * STP;
    float* GO = (float*)(p.ws + WS_GO);
    const int off128 = (16 * wi + c) * 128 + 8 * g, off64 = (16 * wi + c) * 64 + 8 * g, offk = (32 * wi + c) * 64 + 8 * g, offu = (16 * wi + 4 * g) * 128 + 16 * sl + c;
#pragma unroll
    for (int mt = 0; mt < 2; ++mt) *(LAS v2u*)(ST + c * STP + 16 * (2 * wi + mt) + 4 * g) = (v2u){0u, 0u};
    pg8::f32x4 Sacc[2] = {{0.f, 0.f, 0.f, 0.f}, {0.f, 0.f, 0.f, 0.f}};
    __syncthreads();
    GdnFrags F0, F1;
    gdn_load(F0, p, h, off128, off64, offk, offu);
#define GDN_STEP(F, n_) do { const int cur = (n_) & 1; bf16x8_t sf[4]; \
        _Pragma("unroll") for (int ks = 0; ks < 4; ++ks) sf[ks] = *(const LAS bf16x8_t*)(ST + cur * 16 * STP + c * STP + 32 * ks + 8 * g); \
        pg8::f32x4 vn = {F.u[0], F.u[1], F.u[2], F.u[3]}; \
        _Pragma("unroll") for (int ks = 0; ks < 4; ++ks) vn = __builtin_amdgcn_mfma_f32_16x16x32_bf16(F.nw[ks], sf[ks], vn, 0, 0, 0); \
        { v2u w; w.x = pk2(vn[0], vn[1]); w.y = pk2(vn[2], vn[3]); *(LAS v2u*)(VNT + c * VNP + 16 * wi + 4 * g) = w; } \
        LDS_BAR(); \
        const bf16x8_t v0 = *(const LAS bf16x8_t*)(VNT + c * VNP + 8 * g), v1 = *(const LAS bf16x8_t*)(VNT + c * VNP + 32 + 8 * g); \
        pg8::f32x4 o = {0.f, 0.f, 0.f, 0.f}; \
        _Pragma("unroll") for (int ks = 0; ks < 4; ++ks) o = __builtin_amdgcn_mfma_f32_16x16x32_bf16(F.qg[ks], sf[ks], o, 0, 0, 0); \
        o = __builtin_amdgcn_mfma_f32_16x16x32_bf16(F.at[0], v0, o, 0, 0, 0); o = __builtin_amdgcn_mfma_f32_16x16x32_bf16(F.at[1], v1, o, 0, 0, 0); \
        { const size_t tb = (size_t)(n_) * 64 + 16 * wi + 4 * g; _Pragma("unroll") for (int r = 0; r < 4; ++r) GO[(tb + r) * BW + h * 128 + 16 * sl + c] = o[r]; } \
        _Pragma("unroll") for (int mt = 0; mt < 2; ++mt) { Sacc[mt] = Sacc[mt] * F.dl; \
            Sacc[mt] = __builtin_amdgcn_mfma_f32_16x16x32_bf16(F.kt[mt][0], v0, Sacc[mt], 0, 0, 0); Sacc[mt] = __builtin_amdgcn_mfma_f32_16x16x32_bf16(F.kt[mt][1], v1, Sacc[mt], 0, 0, 0); \
            v2u w; w.x = pk2(Sacc[mt][0], Sacc[mt][1]); w.y = pk2(Sacc[mt][2], Sacc[mt][3]); *(LAS v2u*)(ST + (cur ^ 1) * 16 * STP + c * STP + 16 * (2 * wi + mt) + 4 * g) = w; } \
        LDS_BAR(); } while (0)
    for (int n = 0; n < T / 64; n += 2) {
        gdn_load(F1, p, (n + 1) * 4 + h, off128, off64, offk, offu);
        GDN_STEP(F0, n);
        gdn_load(F0, p, ((n + 2 < T / 64) ? n + 2 : n) * 4 + h, off128, off64, offk, offu);
        GDN_STEP(F1, n + 1);
    }
#undef GDN_STEP
}

constexpr int SEQ_UOFF = 132096;
constexpr int GI_NW = 0, GI_QG = 8704, GI_AT = 17408, GI_KT = 22016, GI_SZ = 31232;
struct GdnStage { v4u r[7]; float u[4]; float dl; };
__device__ __forceinline__ void gdn_stage_load(GdnStage& Sg, const Params& p, int item, int tid, int offu) {
    const bf16* GNW = (const bf16*)(p.ws + WS_GNW) + (size_t)item * 8192; const bf16* GQG = (const bf16*)(p.ws + WS_GQG) + (size_t)item * 8192;
    const bf16* GAT = (const bf16*)(p.ws + WS_GAT) + (size_t)item * 4096; const bf16* GKT = (const bf16*)(p.ws + WS_GKT) + (size_t)item * 8192; const float* GU = (const float*)(p.ws + WS_GU) + (size_t)item * 8192;
    Sg.r[0] = *(const v4u*)(GNW + 8 * tid); Sg.r[1] = *(const v4u*)(GNW + 8 * (tid + 512)); Sg.r[2] = *(const v4u*)(GQG + 8 * tid); Sg.r[3] = *(const v4u*)(GQG + 8 * (tid + 512));
    Sg.r[4] = *(const v4u*)(GAT + 8 * tid); Sg.r[5] = *(const v4u*)(GKT + 8 * tid); Sg.r[6] = *(const v4u*)(GKT + 8 * (tid + 512));
#pragma unroll
    for (int r = 0; r < 4; ++r) Sg.u[r] = GU[offu + r * 128];
    Sg.dl = ((const float*)(p.ws + WS_GDL))[item];
}
__device__ __forceinline__ void gdn_stage_write(const GdnStage& Sg, LAS unsigned short* img, int tid) {
    { const int p0 = tid, p1 = tid + 512;
      *(LAS v4u*)(img + GI_NW + (p0 >> 4) * 136 + 8 * (p0 & 15)) = Sg.r[0]; *(LAS v4u*)(img + GI_NW + (p1 >> 4) * 136 + 8 * (p1 & 15)) = Sg.r[1];
      *(LAS v4u*)(img + GI_QG + (p0 >> 4) * 136 + 8 * (p0 & 15)) = Sg.r[2]; *(LAS v4u*)(img + GI_QG + (p1 >> 4) * 136 + 8 * (p1 & 15)) = Sg.r[3];
      *(LAS v4u*)(img + GI_AT + (p0 >> 3) * 72 + 8 * (p0 & 7)) = Sg.r[4];
      *(LAS v4u*)(img + GI_KT + (p0 >> 3) * 72 + 8 * (p0 & 7)) = Sg.r[5]; *(LAS v4u*)(img + GI_KT + (p1 >> 3) * 72 + 8 * (p1 & 7)) = Sg.r[6]; }
}
__device__ __forceinline__ void gdn_seq2(const Params& p, LAS unsigned char* lds, int wgi, int tid, int wave, int lane) {
    const int h = wgi >> 2, sl = 2 * (wgi & 3) + (wave >> 2), wi = wave & 3, g = lane >> 4, c = lane & 15;
    LAS unsigned short* IMG = (LAS unsigned short*)lds;
    LAS unsigned short* ST = (LAS unsigned short*)(lds + SEQ_UOFF + (wave >> 2) * 12288);
    LAS unsigned short* VNT = ST + 2 * 16 * STP;
    float* GO = (float*)(p.ws + WS_GO);
    const int offu = (16 * wi + 4 * g) * 128 + 16 * sl + c;
#pragma unroll
    for (int mt = 0; mt < 2; ++mt) *(LAS v2u*)(ST + c * STP + 16 * (2 * wi + mt) + 4 * g) = (v2u){0u, 0u};
    pg8::f32x4 Sacc[2] = {{0.f, 0.f, 0.f, 0.f}, {0.f, 0.f, 0.f, 0.f}};
    GdnStage A, B;
    gdn_stage_load(A, p, h, tid, offu); gdn_stage_write(A, IMG, tid);
    gdn_stage_load(B, p, 4 + h, tid, offu);
    LDS_BAR();
    constexpr int NCH = T / 64;
#define GDN_STEP2(X, Y, n_) do { const int cur = (n_) & 1; const LAS unsigned short* im = IMG + cur * GI_SZ; bf16x8_t sf[4]; \
        _Pragma("unroll") for (int ks = 0; ks < 4; ++ks) sf[ks] = *(const LAS bf16x8_t*)(ST + cur * 16 * STP + c * STP + 32 * ks + 8 * g); \
        pg8::f32x4 vn = {X.u[0], X.u[1], X.u[2], X.u[3]}; const float dl = X.dl; \
        _Pragma("unroll") for (int ks = 0; ks < 4; ++ks) vn = __builtin_amdgcn_mfma_f32_16x16x32_bf16(*(const LAS bf16x8_t*)(im + GI_NW + (16 * wi + c) * 136 + 32 * ks + 8 * g), sf[ks], vn, 0, 0, 0); \
        { v2u w; w.x = pk2(vn[0], vn[1]); w.y = pk2(vn[2], vn[3]); *(LAS v2u*)(VNT + c * VNP + 16 * wi + 4 * g) = w; } \
        pg8::f32x4 o = {0.f, 0.f, 0.f, 0.f}; \
        _Pragma("unroll") for (int ks = 0; ks < 4; ++ks) o = __builtin_amdgcn_mfma_f32_16x16x32_bf16(*(const LAS bf16x8_t*)(im + GI_QG + (16 * wi + c) * 136 + 32 * ks + 8 * g), sf[ks], o, 0, 0, 0); \
        LDS_BAR(); \
        gdn_stage_load(X, p, (((n_) + 2 < NCH) ? (n_) + 2 : (n_)) * 4 + h, tid, offu); \
        const bf16x8_t v0 = *(const LAS bf16x8_t*)(VNT + c * VNP + 8 * g), v1 = *(const LAS bf16x8_t*)(VNT + c * VNP + 32 + 8 * g); \
        o = __builtin_amdgcn_mfma_f32_16x16x32_bf16(*(const LAS bf16x8_t*)(im + GI_AT + (16 * wi + c) * 72 + 8 * g), v0, o, 0, 0, 0); \
        o = __builtin_amdgcn_mfma_f32_16x16x32_bf16(*(const LAS bf16x8_t*)(im + GI_AT + (16 * wi + c) * 72 + 32 + 8 * g), v1, o, 0, 0, 0); \
        { const size_t tb = (size_t)(n_) * 64 + 16 * wi + 4 * g; _Pragma("unroll") for (int r = 0; r < 4; ++r) GO[(tb + r) * BW + h * 128 + 16 * sl + c] = o[r]; } \
        _Pragma("unroll") for (int mt = 0; mt < 2; ++mt) { Sacc[mt] = Sacc[mt] * dl; \
            Sacc[mt] = __builtin_amdgcn_mfma_f32_16x16x32_bf16(*(const LAS bf16x8_t*)(im + GI_KT + (16 * (2 * wi + mt) + c) * 72 + 8 * g), v0, Sacc[mt], 0, 0, 0); \
            Sacc[mt] = __builtin_amdgcn_mfma_f32_16x16x32_bf16(*(const LAS bf16x8_t*)(im + GI_KT + (16 * (2 * wi + mt) + c) * 72 + 32 + 8 * g), v1, Sacc[mt], 0, 0, 0); \
            v2u w; w.x = pk2(Sacc[mt][0], Sacc[mt][1]); w.y = pk2(Sacc[mt][2], Sacc[mt][3]); *(LAS v2u*)(ST + (cur ^ 1) * 16 * STP + c * STP + 16 * (2 * wi + mt) + 4 * g) = w; } \
        gdn_stage_write(Y, IMG + (cur ^ 1) * GI_SZ, tid); \
        LDS_BAR(); } while (0)
    for (int n = 0; n < NCH; n += 2) { GDN_STEP2(A, B, n); GDN_STEP2(B, A, n + 1); }
#undef GDN_STEP2
}
constexpr int MI_Q = 0, MI_S = 4608, MI_K = 9216, MI_SZ = 13824;
struct MlStage { v4u r[3]; bf16x8_t vt[2]; float fl; };
__device__ __forceinline__ void ml_stage_load(MlStage& Sg, const Params& p, int item, int tid, int offV) {
    const bf16* MQ = (const bf16*)(p.ws + WS_MQ) + (size_t)item * 4096; const bf16* MS = (const bf16*)(p.ws + WS_MS) + (size_t)item * 4096; const bf16* MK = (const bf16*)(p.ws + WS_MK) + (size_t)item * 4096;
    const bf16* MV = (const bf16*)(p.ws + WS_MV) + (size_t)item * 9216;
    Sg.r[0] = *(const v4u*)(MQ + 8 * tid); Sg.r[1] = *(const v4u*)(MS + 8 * tid); Sg.r[2] = *(const v4u*)(MK + 8 * tid);
    Sg.vt[0] = *(const bf16x8_t*)(MV + offV); Sg.vt[1] = *(const bf16x8_t*)(MV + offV + 32);
    Sg.fl = ((const float*)(p.ws + WS_MFL))[item];
}
__device__ __forceinline__ void ml_stage_write(const MlStage& Sg, LAS unsigned short* img, int tid) {
    const int o = (tid >> 3) * 72 + 8 * (tid & 7);
    *(LAS v4u*)(img + MI_Q + o) = Sg.r[0]; *(LAS v4u*)(img + MI_S + o) = Sg.r[1]; *(LAS v4u*)(img + MI_K + o) = Sg.r[2];
}
__device__ __forceinline__ void ml_seq2(const Params& p, LAS unsigned char* lds, int wgi, int tid, int wave, int lane) {
    const int h = wgi / 5, sl0 = 2 * (wgi % 5) + (wave >> 2), wi = wave & 3, g = lane >> 4, c = lane & 15;
    const bool real = sl0 < 9; const int sl = real ? sl0 : 8;
    LAS unsigned short* IMG = (LAS unsigned short*)lds;
    LAS unsigned short* CT = (LAS unsigned short*)(lds + SEQ_UOFF + (wave >> 2) * 8192);
    float* HO = (float*)(p.ws + WS_HO); float* HDEN = (float*)(p.ws + WS_HDEN);
    const int offV = (16 * sl + c) * 64 + 8 * g;
    *(LAS v2u*)(CT + c * 72 + 16 * wi + 4 * g) = (v2u){0u, 0u};
    pg8::f32x4 Cacc = {0.f, 0.f, 0.f, 0.f};
    MlStage A, B;
    ml_stage_load(A, p, h, tid, offV); ml_stage_write(A, IMG, tid);
    ml_stage_load(B, p, 4 + h, tid, offV);
    LDS_BAR();
    constexpr int NCH = T / 64;
#define ML_STEP2(X, Y, n_) do { const int cur = (n_) & 1; const LAS unsigned short* im = IMG + cur * MI_SZ; const int ro = (16 * wi + c) * 72 + 8 * g; \
        const bf16x8_t c0 = *(const LAS bf16x8_t*)(CT + cur * 16 * 72 + c * 72 + 8 * g), c1 = *(const LAS bf16x8_t*)(CT + cur * 16 * 72 + c * 72 + 32 + 8 * g); \
        const bf16x8_t vt0 = X.vt[0], vt1 = X.vt[1]; const float fl = X.fl; \
        pg8::f32x4 num = {0.f, 0.f, 0.f, 0.f}; \
        num = __builtin_amdgcn_mfma_f32_16x16x32_bf16(*(const LAS bf16x8_t*)(im + MI_Q + ro), c0, num, 0, 0, 0); num = __builtin_amdgcn_mfma_f32_16x16x32_bf16(*(const LAS bf16x8_t*)(im + MI_Q + ro + 32), c1, num, 0, 0, 0); \
        num = __builtin_amdgcn_mfma_f32_16x16x32_bf16(*(const LAS bf16x8_t*)(im + MI_S + ro), vt0, num, 0, 0, 0); num = __builtin_amdgcn_mfma_f32_16x16x32_bf16(*(const LAS bf16x8_t*)(im + MI_S + ro + 32), vt1, num, 0, 0, 0); \
        Cacc = Cacc * fl; \
        Cacc = __builtin_amdgcn_mfma_f32_16x16x32_bf16(*(const LAS bf16x8_t*)(im + MI_K + ro), vt0, Cacc, 0, 0, 0); Cacc = __builtin_amdgcn_mfma_f32_16x16x32_bf16(*(const LAS bf16x8_t*)(im + MI_K + ro + 32), vt1, Cacc, 0, 0, 0); \
        ml_stage_load(X, p, (((n_) + 2 < NCH) ? (n_) + 2 : (n_)) * 4 + h, tid, offV); \
        { v2u w; w.x = pk2(Cacc[0], Cacc[1]); w.y = pk2(Cacc[2], Cacc[3]); *(LAS v2u*)(CT + (cur ^ 1) * 16 * 72 + c * 72 + 16 * wi + 4 * g) = w; } \
        { const size_t tb = (size_t)(n_) * 64 + 16 * wi + 4 * g; \
          if (sl < 8) { _Pragma("unroll") for (int r = 0; r < 4; ++r) HO[(tb + r) * BW + h * 128 + 16 * sl + c] = num[r]; } \
          else if (c == 0 && real) { _Pragma("unroll") for (int r = 0; r < 4; ++r) HDEN[(tb + r) * 4 + h] = num[r]; } } \
        ml_stage_write(Y, IMG + (cur ^ 1) * MI_SZ, tid); \
        LDS_BAR(); } while (0)
    for (int n = 0; n < NCH; n += 2) { ML_STEP2(A, B, n); ML_STEP2(B, A, n + 1); }
#undef ML_STEP2
}

__device__ __forceinline__ void mixer_gmlp_item(const Params& p, int l, LAS unsigned char* lds, int item, int tid, int wave, int lane) {
    const int chunk = item >> 2, g = item & 3; const size_t tok0 = (size_t)chunk * 128;
    const bf16* Z = (const bf16*)(p.ws + WS_Z);
    const float* ng = p.in[I_GMNG] + l * BW; const float* nb = p.in[I_GMNB] + l * BW;
    const float* wsp = p.in[I_GMWS] + ((size_t)(l * 4 + g) * 128) * 128; const float* bsp = p.in[I_GMBS] + (l * 4 + g) * 128;
    LAS unsigned short* vT = (LAS unsigned short*)lds;
    {   v4u raw[16];
#pragma unroll
        for (int r = 0; r < 16; ++r) raw[r] = *(const v4u*)(Z + (tok0 + wave * 16 + r) * ZC + ZC_GMV + 8 * lane);
        float gn[8], gb[8];
#pragma unroll
        for (int i = 0; i < 8; ++i) { gn[i] = ng[8 * lane + i]; gb[i] = nb[8 * lane + i]; }
#pragma unroll
        for (int r = 0; r < 16; ++r) { const int tk = wave * 16 + r; float x[8]; unpack8(raw[r], x); float s = 0.f;
#pragma unroll
            for (int i = 0; i < 8; ++i) { x[i] = gelu_tanh(x[i]); s += x[i]; }
            const float mean = wave_sum(s) * (1.f / 512.f); float ss = 0.f;
#pragma unroll
            for (int i = 0; i < 8; ++i) { x[i] -= mean; ss += x[i] * x[i]; }
            const float rstd = rsqrtf(wave_sum(ss) * (1.f / 512.f) + LN_EPS);
            if ((lane >> 4) == g) { const int cl = 8 * (lane & 15);
#pragma unroll
                for (int i = 0; i < 8; ++i) vT[(cl + i) * 136 + tk] = (unsigned short)f2bf(x[i] * rstd * gn[i] + gb[i]); } } }
    __syncthreads();
    {   const int c16 = lane & 15, g4 = lane >> 4, t = 16 * wave + c16, nks = ((16 * wave + 15) >> 5) + 1;
        bf16x8_t wf[4];
#pragma unroll
        for (int ks = 0; ks < 4; ++ks) { wf[ks] = (bf16x8_t){0, 0, 0, 0, 0, 0, 0, 0};
            if (ks < nks) { const float* wp = wsp + (size_t)t * 128 + 32 * ks + 8 * g4; const v4f a = *(const v4f*)wp, b = *(const v4f*)(wp + 4); const int s0 = 32 * ks + 8 * g4;
                const v4u w = (v4u){pk2(s0 <= t ? a.x : 0.f, s0 + 1 <= t ? a.y : 0.f), pk2(s0 + 2 <= t ? a.z : 0.f, s0 + 3 <= t ? a.w : 0.f), pk2(s0 + 4 <= t ? b.x : 0.f, s0 + 5 <= t ? b.y : 0.f), pk2(s0 + 6 <= t ? b.z : 0.f, s0 + 7 <= t ? b.w : 0.f)};
                wf[ks] = __builtin_bit_cast(bf16x8_t, w); } }
        pg8::f32x4 acc[8];
#pragma unroll
        for (int ct = 0; ct < 8; ++ct) acc[ct] = (pg8::f32x4){0.f, 0.f, 0.f, 0.f};
#pragma unroll
        for (int ks = 0; ks < 4; ++ks) { if (ks < nks) {
#pragma unroll
            for (int ct = 0; ct < 8; ++ct) acc[ct] = __builtin_amdgcn_mfma_f32_16x16x32_bf16(*(const LAS bf16x8_t*)(vT + (16 * ct + c16) * 136 + 32 * ks + 8 * g4), wf[ks], acc[ct], 0, 0, 0); } }
        const float bias = bsp[t]; v2u ur[8];
#pragma unroll
        for (int ct = 0; ct < 8; ++ct) ur[ct] = *(const v2u*)(Z + (tok0 + t) * ZC + ZC_GMU + g * 128 + 16 * ct + 4 * g4);
#pragma unroll
        for (int ct = 0; ct < 8; ++ct) { const float u0 = bflo(ur[ct].x), u1 = bfhi(ur[ct].x), u2 = bflo(ur[ct].y), u3 = bfhi(ur[ct].y);
            const float o0 = gelu_tanh(u0) * (acc[ct][0] + bias), o1 = gelu_tanh(u1) * (acc[ct][1] + bias), o2 = gelu_tanh(u2) * (acc[ct][2] + bias), o3 = gelu_tanh(u3) * (acc[ct][3] + bias);
#if MERGE_FP8
            *(unsigned*)((unsigned char*)(p.ws + WS_BR) + (tok0 + t) * BRW + 1 * BW + g * 128 + 16 * ct + 4 * g4) = pk4_f8(o0, o1, o2, o3, BRSC); }
#else
            *(v2u*)((bf16*)(p.ws + WS_BR) + (tok0 + t) * BRW + 1 * BW + g * 128 + 16 * ct + 4 * g4) = (v2u){pk2(o0, o1), pk2(o2, o3)}; }
#endif
    }
    __syncthreads();
}

__device__ __forceinline__ void vt_item(const Params& p, LAS unsigned char* lds, int item, int tid) {
    const int h = item & 3, n = item >> 2; const size_t t0 = (size_t)n * 64;
    const bf16* Z = (const bf16*)(p.ws + WS_Z); bf16* VT = (bf16*)(p.ws + WS_VT);
    LAS unsigned short* vs = (LAS unsigned short*)lds;
#pragma unroll
    for (int r = 0; r < 2; ++r) { const int idx = tid + 512 * r, tk = idx >> 4, c8 = idx & 15;
        *(LAS v4u*)(vs + tk * 136 + 8 * c8) = *(const v4u*)(Z + (t0 + tk) * ZC + ZC_SBV + h * 128 + 8 * c8); }
    __syncthreads();
    { const int d = tid >> 2, jq = tid & 3; unsigned w[8];
#pragma unroll
      for (int x = 0; x < 8; ++x) w[x] = (unsigned)vs[(16 * jq + 2 * x) * 136 + d] | ((unsigned)vs[(16 * jq + 2 * x + 1) * 136 + d] << 16);
      bf16* dst = VT + ((size_t)h * 128 + d) * T + t0 + 16 * jq;
      *(v4u*)dst = (v4u){w[0], w[1], w[2], w[3]}; *(v4u*)(dst + 8) = (v4u){w[4], w[5], w[6], w[7]}; }
    __syncthreads();
}
constexpr int KTP = 136, VTP = 72;
__device__ __forceinline__ void sb_unit(const Params& p, LAS unsigned char* lds, int unit, int tid, int wave, int lane) {
    const int h = unit >> 6, q0 = (unit & 63) * 128, g = lane >> 4, c = lane & 15; const int qrow = q0 + 16 * wave + c;
    const bf16* Z = (const bf16*)(p.ws + WS_Z); const bf16* VT = (const bf16*)(p.ws + WS_VT) + (size_t)h * 128 * T; bf16* BR0 = (bf16*)(p.ws + WS_BR);
    LAS unsigned short* Kt = (LAS unsigned short*)lds;
    LAS unsigned short* Vt = Kt + 2 * 64 * KTP;
    LAS int* flags = (LAS int*)(Vt + 2 * 128 * VTP);
    bf16x8_t qf[4];
#pragma unroll
    for (int ks = 0; ks < 4; ++ks) qf[ks] = *(const bf16x8_t*)(Z + (size_t)qrow * ZC + ZC_SBQ + h * 128 + 32 * ks + 8 * g);
    pg8::f32x4 acc[8];
#pragma unroll
    for (int dt = 0; dt < 8; ++dt) acc[dt] = (pg8::f32x4){0.f, 0.f, 0.f, 0.f};
    float racc = 0.f;
    v4u kr[2], vr[2];
    const int jt = (q0 >> 6) + 1;
#define SB_GLOAD(j_) do { _Pragma("unroll") for (int r = 0; r < 2; ++r) { const int idx = tid + 512 * r; \
        kr[r] = *(const v4u*)(Z + (size_t)(64 * (j_) + (idx >> 4)) * ZC + ZC_SBK + h * 128 + 8 * (idx & 15)); \
        vr[r] = *(const v4u*)(VT + (size_t)(idx >> 3) * T + 64 * (j_) + 8 * (idx & 7)); } } while (0)
#define SB_LWRITE(b_) do { _Pragma("unroll") for (int r = 0; r < 2; ++r) { const int idx = tid + 512 * r; \
        *(LAS v4u*)(Kt + (b_) * 64 * KTP + (idx >> 4) * KTP + 8 * (idx & 15)) = kr[r]; *(LAS v4u*)(Vt + (b_) * 128 * VTP + (idx >> 3) * VTP + 8 * (idx & 7)) = vr[r]; } } while (0)
    LDS_BAR();
    SB_GLOAD(jt); SB_LWRITE(0);
    LDS_BAR();
    for (int j = jt, it = 0; j >= 0; --j, ++it) {
        const int cur = it & 1;
        SB_GLOAD(j > 0 ? j - 1 : 0);
        const bool wdone = __all(racc > 104.f);
        if (64 * j < q0 + 16 * wave + 15 && !wdone) {
            const LAS unsigned short* Kc = Kt + cur * 64 * KTP; const LAS unsigned short* Vc = Vt + cur * 128 * VTP;
            pg8::f32x4 z[4];
#pragma unroll
            for (int s = 0; s < 4; ++s) { z[s] = (pg8::f32x4){0.f, 0.f, 0.f, 0.f};
#pragma unroll
                for (int ks = 0; ks < 4; ++ks) z[s] = __builtin_amdgcn_mfma_f32_16x16x32_bf16(*(const LAS bf16x8_t*)(Kc + (16 * s + c) * KTP + 32 * ks + 8 * g), qf[ks], z[s], 0, 0, 0); }
            float sp[4][4], t[4], xs[4]; bool mk[4][4];
#pragma unroll
            for (int s = 0; s < 4; ++s) { t[s] = 0.f;
#pragma unroll
                for (int r = 0; r < 4; ++r) { const int key = 64 * j + 16 * s + 4 * g + r; mk[s][r] = key < qrow; const float zz = z[s][r] * 0.08838834764831845f; z[s][r] = zz;
                    sp[s][r] = mk[s][r] ? softplusf_(zz) : 0.f; t[s] += sp[s][r]; } }
            float grand = 0.f, higher[4];
#pragma unroll
            for (int s = 3; s >= 0; --s) { float x = t[s]; float y = __shfl(x, lane + 16); x += (g < 3) ? y : 0.f; y = __shfl(x, lane + 32); x += (g < 2) ? y : 0.f;
                xs[s] = x - t[s];
                const float tot = __shfl(x, c); higher[s] = grand; grand += tot; }
            bf16x8_t pf[2];
#pragma unroll
            for (int s = 0; s < 4; ++s) { float a[4]; float e = 0.f;
#pragma unroll
                for (int r = 3; r >= 0; --r) { const float la = z[s][r] - sp[s][r] - (racc + higher[s] + xs[s] + e); a[r] = mk[s][r] ? __expf(la) : 0.f; e += sp[s][r]; }
                const unsigned w0 = pk2(a[0], a[1]), w1 = pk2(a[2], a[3]);
                if ((s & 1) == 0) { pf[s >> 1][0] = (short)(w0 & 0xffff); pf[s >> 1][1] = (short)(w0 >> 16); pf[s >> 1][2] = (short)(w1 & 0xffff); pf[s >> 1][3] = (short)(w1 >> 16); }
                else              { pf[s >> 1][4] = (short)(w0 & 0xffff); pf[s >> 1][5] = (short)(w0 >> 16); pf[s >> 1][6] = (short)(w1 & 0xffff); pf[s >> 1][7] = (short)(w1 >> 16); } }
            racc += grand;
#pragma unroll
            for (int dt = 0; dt < 8; ++dt)
#pragma unroll
                for (int k2 = 0; k2 < 2; ++k2) { const v2u lo = *(const LAS v2u*)(Vc + (16 * dt + c) * VTP + 32 * k2 + 4 * g), hi = *(const LAS v2u*)(Vc + (16 * dt + c) * VTP + 32 * k2 + 16 + 4 * g);
                    const v4u vv = (v4u){lo.x, lo.y, hi.x, hi.y};
                    acc[dt] = __builtin_amdgcn_mfma_f32_16x16x32_bf16(__builtin_bit_cast(bf16x8_t, vv), pf[k2], acc[dt], 0, 0, 0); }
        }
        const bool wd2 = __all(racc > 104.f);
        if (lane == 0) flags[cur * 8 + wave] = wd2 ? 1 : 0;
        SB_LWRITE(cur ^ 1);
        LDS_BAR();
        int alld = 1;
#pragma unroll
        for (int w = 0; w < 8; ++w) alld &= flags[cur * 8 + w];
        if (alld) break;
    }
#undef SB_GLOAD
#undef SB_LWRITE
#pragma unroll
#if MERGE_FP8
    for (int dt = 0; dt < 8; ++dt) *(unsigned*)((unsigned char*)BR0 + (size_t)qrow * BRW + h * 128 + 16 * dt + 4 * g) = pk4_f8(acc[dt][0], acc[dt][1], acc[dt][2], acc[dt][3], BRSC);
#else
    for (int dt = 0; dt < 8; ++dt) { v2u w; w.x = pk2(acc[dt][0], acc[dt][1]); w.y = pk2(acc[dt][2], acc[dt][3]); *(v2u*)(BR0 + (size_t)qrow * BRW + h * 128 + 16 * dt + 4 * g) = w; }
#endif
}

struct GateOrder {
    pg8::StaticOrder s; int pn0;
    __device__ __forceinline__ bool next(int i, pg8::Unit& u) const { if (!s.next(i, u)) return false; u.pn += pn0; return true; }
    __device__ __forceinline__ void a_ready(const pg8::Unit&) const {}
    __device__ __forceinline__ void done(const pg8::Unit&) const {}
};
constexpr int GATE_PN0 = ZC_GATE / 256, GATE_WGS = 128;
__device__ __forceinline__ void phase_mixers(const Params& p, int l, LAS unsigned char* lds, int wg, int G, int tid, int wave, int lane, const XcdBarrier& bar) {
#if defined(PROBE_SPLIT)
    if (wg < 16) gdn_seq2(p, lds, wg, tid, wave, lane); else if (wg < 36) ml_seq2(p, lds, wg - 16, tid, wave, lane);
    xcd_barrier(bar);
    const int w2 = wg, G2 = G;
#else
    if (wg < 16) { gdn_seq2(p, lds, wg, tid, wave, lane); return; }
    if (wg < 36) { ml_seq2(p, lds, wg - 16, tid, wave, lane); return; }
    const int w2 = wg - 36, G2 = G - 36;
#endif
    if (GATE_SPLIT && G == 256) {
        if (w2 < GATE_WGS) {
            for (int it = w2; it < 256; it += GATE_WGS) mixer_gmlp_item(p, l, lds, it, tid, wave, lane);
            for (int it = w2; it < 256; it += GATE_WGS) sb_unit(p, lds, it, tid, wave, lane);
            __syncthreads();
            pg8::Gemm g{(const bf16*)(p.ws + WS_XB), (const bf16*)(p.ws + WS_WIN), T, ZC, D / 2, D / 2, D / 2}; GateOrder S; S.s.init(T, ZC - ZC_GATE, GATE_WGS, w2); S.pn0 = GATE_PN0;
#if GATE_FP8
            EpiGate8 E{p.ws + WS_MTMP, 1.f / 64.f};
            pg8::gemm_phase<EpiGate8, GateOrder, true, true, true>(lds, g, S, E);
#else
            pg8::EpiBf16<0> E{(bf16*)(p.ws + WS_Z), ZC, nullptr, 0, 0, 1.f / 64.f};
            pg8::gemm_phase<pg8::EpiBf16<0>, GateOrder, true, true, true>(lds, g, S, E);
#endif
        } else { const int w3 = w2 - GATE_WGS, G3 = G2 - GATE_WGS; __syncthreads();
            phase_convert<1>(p, l, lds, w3 * 8 + wave, G3 * 8, wave, lane); }
        return; }
    for (int it = w2; it < 256; it += G2) mixer_gmlp_item(p, l, lds, it, tid, wave, lane);
    for (int it = w2; it < 256; it += G2) sb_unit(p, lds, it, tid, wave, lane);
#if !defined(PROBE_CONV0)
    __syncthreads();
    {
        constexpr int NIT1 = (NEX * 2 * (D / 64) * (ED / 32)) + (NEX * (ED / 64) * (D / 32));
        const int nheavy = (G2 < 256 && 2 * G2 >= 256) ? 256 - G2 : 0, per_wave = NIT1 / (G2 * 8);
        const int NA = (nheavy > 0 && per_wave > 2 * CONV_SKIP) ? (per_wave - CONV_SKIP) * (G2 * 8) : NIT1;
        phase_convert<1>(p, l, lds, w2 * 8 + wave, G2 * 8, wave, lane, false, 0, NA);
        if (NA < NIT1 && w2 >= nheavy) phase_convert<1>(p, l, lds, (w2 - nheavy) * 8 + wave, (G2 - nheavy) * 8, wave, lane, false, NA, NIT1); }
#endif
}

__device__ __forceinline__ void phase_post(const Params& p, int l, int gw, int NGW, int lane) {
    const bf16* Z = (const bf16*)(p.ws + WS_Z); const float* GO = (const float*)(p.ws + WS_GO); const float* HO = (const float*)(p.ws + WS_HO); const float* HDEN = (const float*)(p.ws + WS_HDEN);
    bf16* BR2 = (bf16*)(p.ws + WS_BR) + 2 * BW; bf16* BR3 = (bf16*)(p.ws + WS_BR) + 3 * BW;
    const float* gng = p.in[I_GDNNG] + l * 128; const float* mng = p.in[I_MLNG] + l * BW;
    for (int t = gw; t < T; t += NGW) {
        {   const v4f a0 = *(const v4f*)(GO + (size_t)t * BW + 8 * lane), a1 = *(const v4f*)(GO + (size_t)t * BW + 8 * lane + 4); float o[8] = {a0.x, a0.y, a0.z, a0.w, a1.x, a1.y, a1.z, a1.w}; float ss = 0.f;
#pragma unroll
            for (int i = 0; i < 8; ++i) ss += o[i] * o[i];
            const float r = rsqrtf(sum16(ss) * (1.f / 128.f) + LN_EPS);
            const v4u graw = *(const v4u*)(Z + (size_t)t * ZC + ZC_GDNG + 8 * lane); float gt[8]; unpack8(graw, gt);
#pragma unroll
            for (int i = 0; i < 8; ++i) o[i] = o[i] * r * gng[(8 * lane + i) & 127] * siluf_(gt[i]);
#if MERGE_FP8
            *(v2u*)((unsigned char*)(p.ws + WS_BR) + (size_t)t * BRW + 2 * BW + 8 * lane) = (v2u){pk4_f8(o[0], o[1], o[2], o[3], BRSC), pk4_f8(o[4], o[5], o[6], o[7], BRSC)}; }
#else
            v4u w; w.x = pk2(o[0], o[1]); w.y = pk2(o[2], o[3]); w.z = pk2(o[4], o[5]); w.w = pk2(o[6], o[7]); *(v4u*)(BR2 + (size_t)t * BRW + 8 * lane) = w; }
#endif
        {   const v4f a0 = *(const v4f*)(HO + (size_t)t * BW + 8 * lane), a1 = *(const v4f*)(HO + (size_t)t * BW + 8 * lane + 4); float o[8] = {a0.x, a0.y, a0.z, a0.w, a1.x, a1.y, a1.z, a1.w}; float ss = 0.f;
            const float dn = __builtin_amdgcn_rcpf(fmaxf(fabsf(HDEN[(size_t)t * 4 + (lane >> 4)]), 1.f));
#pragma unroll
            for (int i = 0; i < 8; ++i) { o[i] *= dn; ss += o[i] * o[i]; }
            const float r = rsqrtf(sum16(ss) * (1.f / 128.f) + LN_EPS);
            const v4u graw = *(const v4u*)(Z + (size_t)t * ZC + ZC_MLO + 8 * lane); float gt[8]; unpack8(graw, gt);
#pragma unroll
            for (int i = 0; i < 8; ++i) o[i] = o[i] * r * mng[8 * lane + i] * sigmoidf_(gt[i]);
#if MERGE_FP8
            *(v2u*)((unsigned char*)(p.ws + WS_BR) + (size_t)t * BRW + 3 * BW + 8 * lane) = (v2u){pk4_f8(o[0], o[1], o[2], o[3], BRSC), pk4_f8(o[4], o[5], o[6], o[7], BRSC)}; }
#else
            v4u w; w.x = pk2(o[0], o[1]); w.y = pk2(o[2], o[3]); w.z = pk2(o[4], o[5]); w.w = pk2(o[6], o[7]); *(v4u*)(BR3 + (size_t)t * BRW + 8 * lane) = w; }
#endif
    }
}

__device__ __forceinline__ void ln_row(const float* yrow, const float* g, const float* b, int lane, v4f (&v)[8]) {
    const v4f* yr = (const v4f*)yrow + lane; float s = 0.f;
#pragma unroll
    for (int j = 0; j < 8; ++j) { v[j] = yr[64 * j]; s += (v[j].x + v[j].y) + (v[j].z + v[j].w); }
    const float mean = wave_sum(s) * (1.f / D); float s2 = 0.f;
#pragma unroll
    for (int j = 0; j < 8; ++j) { v[j] = v[j] - mean; s2 += (v[j].x * v[j].x + v[j].y * v[j].y) + (v[j].z * v[j].z + v[j].w * v[j].w); }
    const float rstd = rsqrtf(wave_sum(s2) * (1.f / D) + LN_EPS);
#pragma unroll
    for (int j = 0; j < 8; ++j) { const v4f gg = ((const v4f*)g)[lane + 64 * j], bb = ((const v4f*)b)[lane + 64 * j]; v[j] = v[j] * rstd * gg + bb; }
}
constexpr int RT_XP = 2052;
constexpr int RT_TAB = 131072 + 1024;
__device__ __forceinline__ void phase_ln1_router(const Params& p, int l, LAS unsigned char* lds, int wg, int G, int wave, int lane, int cnt_shift = 0) {
    const bf16* Y = (const bf16*)(p.ws + WS_Y); bf16* X1 = (bf16*)(p.ws + WS_X1); bf16* X1B = (bf16*)(p.ws + WS_X1B); int* LIST = (int*)(p.ws + WS_LIST); float* WL = (float*)(p.ws + WS_WL); unsigned* SLOT = (unsigned*)(p.ws + WS_SLOT);
    unsigned* cnt = (unsigned*)(p.ws + WS_CTL) + CW_CNT + l * 4096 + cnt_shift;
    const float* g1 = p.in[I_LN1G] + (size_t)l * D; const float* b1 = p.in[I_LN1B] + (size_t)l * D;
    const float* wr = p.in[I_WR] + (size_t)l * D * NE; const float rbias = p.in[I_RB][l * NE + lane];
    LAS float* xt = (LAS float*)lds;
    LAS float* part = (LAS float*)lds;
    LAS unsigned char* selm = lds + RT_TAB; LAS unsigned char* rkm = selm + 4096; LAS float* wtm = (LAS float*)(rkm + 4096); LAS unsigned* basem = (LAS unsigned*)(wtm + 4096);
    const int n_l = lane & 15, kq = lane >> 4;
    int gi = 0;
    for (int tg = wg; tg < T / 16; tg += G, ++gi) {
        {   v4f va[8], vb[8]; const size_t m0 = (size_t)tg * 16 + 2 * wave;
#pragma unroll
            for (int j = 0; j < 8; ++j) { va[j] = ld4(Y, m0 * D + 4 * lane + 256 * j, true); vb[j] = ld4(Y, (m0 + 1) * D + 4 * lane + 256 * j, true); }
            float sa = 0.f, sb = 0.f;
#pragma unroll
            for (int j = 0; j < 8; ++j) { sa += (va[j].x + va[j].y) + (va[j].z + va[j].w); sb += (vb[j].x + vb[j].y) + (vb[j].z + vb[j].w); }
            const float ma = wave_sum(sa) * (1.f / D), mb = wave_sum(sb) * (1.f / D); float qa = 0.f, qb = 0.f;
#pragma unroll
            for (int j = 0; j < 8; ++j) { va[j] = va[j] - ma; vb[j] = vb[j] - mb; qa += (va[j].x * va[j].x + va[j].y * va[j].y) + (va[j].z * va[j].z + va[j].w * va[j].w); qb += (vb[j].x * vb[j].x + vb[j].y * vb[j].y) + (vb[j].z * vb[j].z + vb[j].w * vb[j].w); }
            const float ra = rsqrtf(wave_sum(qa) * (1.f / D) + LN_EPS), rb = rsqrtf(wave_sum(qb) * (1.f / D) + LN_EPS);
#pragma unroll
            for (int j = 0; j < 8; ++j) { const v4f gg = ((const v4f*)g1)[lane + 64 * j], bb = ((const v4f*)b1)[lane + 64 * j]; va[j] = va[j] * ra * gg + bb; vb[j] = vb[j] * rb * gg + bb; }
#pragma unroll
            for (int rr = 0; rr < 2; ++rr) { const size_t m = m0 + rr; v2u* xo = (v2u*)(X1 + m * D) + lane;
#pragma unroll
                for (int j = 0; j < 8; ++j) { const v4f v = rr ? vb[j] : va[j]; xo[64 * j] = (v2u){pk2(v.x, v.y), pk2(v.z, v.w)};
#if MOE_UP_FP8
                    { unsigned w = 0; w = __builtin_amdgcn_cvt_pk_fp8_f32(v.x, v.y, w, false); w = __builtin_amdgcn_cvt_pk_fp8_f32(v.z, v.w, w, true); ((unsigned*)((unsigned char*)X1B + m * D))[lane + 64 * j] = w; }
#else
                    { v2u o; o.x = pk2(v.x, v.y); o.y = pk2(v.z, v.w); ((v2u*)(X1B + m * D))[lane + 64 * j] = o; }
#endif
                    *(LAS v4f*)(xt + (2 * wave + rr) * RT_XP + 4 * lane + 256 * j) = v; } } }
        __syncthreads();
        {   pg8::f32x4 acc[4];
#pragma unroll
            for (int i = 0; i < 4; ++i) acc[i] = (pg8::f32x4){0.f, 0.f, 0.f, 0.f};
            const float* wb = wr + (size_t)(256 * wave + 4 * kq) * NE + 4 * n_l;
            const LAS float* xa = xt + n_l * RT_XP + 256 * wave + 4 * kq;
            v4f bwa[16], bwb[16];
#define RT_LOADW(dst, sb_) do { _Pragma("unroll") for (int q = 0; q < 16; ++q) dst[q] = *(const v4f*)(wb + (size_t)(16 * (4 * (sb_) + (q >> 2)) + (q & 3)) * NE); } while (0)
#define RT_MMA(src, sb_) do { _Pragma("unroll") for (int sg = 0; sg < 4; ++sg) { const v4f a4 = *(const LAS v4f*)(xa + 16 * (4 * (sb_) + sg)); \
                _Pragma("unroll") for (int c = 0; c < 4; ++c) { const v4f b4 = src[sg * 4 + c]; const float a = c == 0 ? a4.x : c == 1 ? a4.y : c == 2 ? a4.z : a4.w; \
                    acc[0] = __builtin_amdgcn_mfma_f32_16x16x4f32(a, b4.x, acc[0], 0, 0, 0); acc[1] = __builtin_amdgcn_mfma_f32_16x16x4f32(a, b4.y, acc[1], 0, 0, 0); \
                    acc[2] = __builtin_amdgcn_mfma_f32_16x16x4f32(a, b4.z, acc[2], 0, 0, 0); acc[3] = __builtin_amdgcn_mfma_f32_16x16x4f32(a, b4.w, acc[3], 0, 0, 0); } } } while (0)
            RT_LOADW(bwa, 0);
#pragma unroll 1
            for (int h = 0; h < 2; ++h) {
                RT_LOADW(bwb, 1); RT_MMA(bwa, 0);
                if (h == 0) RT_LOADW(bwa, 2);
                RT_MMA(bwb, 1);
                wb += (size_t)128 * NE; xa += 128; asm volatile("" : "+v"(wb));
            }
#undef RT_LOADW
#undef RT_MMA
            __syncthreads();
#pragma unroll
            for (int j = 0; j < 4; ++j) *(LAS v4f*)(part + (wave * 16 + 4 * kq + j) * 64 + 4 * n_l) = (v4f){acc[0][j], acc[1][j], acc[2][j], acc[3][j]}; }
        __syncthreads();
#pragma unroll 1
        for (int rr = 0; rr < 2; ++rr) { const int lr = wave + 8 * rr; float logit = 0.f;
#pragma unroll
            for (int w = 0; w < 8; ++w) logit += part[(w * 16 + lr) * 64 + lane];
            const float s = sigmoid_div(logit), biased = s + rbias;
            const float m1 = max8(biased); const float li = (float)(lane & 7);
            const float first = min8(biased == m1 ? li : 8.f);
            const float m2 = max8(li == first ? -INFINITY : biased);
            const float gs = m1 + m2; const int myg = lane >> 3; int grank = 0;
#pragma unroll
            for (int g2 = 0; g2 < 8; ++g2) { const float o = __builtin_bit_cast(float, __builtin_amdgcn_readlane(__builtin_bit_cast(int, gs), g2 * 8)); grank += (o > gs || (o == gs && g2 < myg)) ? 1 : 0; }
            const float masked = grank < 4 ? biased : -INFINITY; int rank = 0;
#pragma unroll 8
            for (int e2 = 0; e2 < 64; ++e2) { const float o = __builtin_bit_cast(float, __builtin_amdgcn_readlane(__builtin_bit_cast(int, masked), e2)); rank += (o > masked || (o == masked && e2 < lane)) ? 1 : 0; }
            const float wsel = rank < 6 ? s : 0.f; const float tot = wave_sum(wsel);
            const int ri = gi * 16 + lr;
            selm[ri * 64 + lane] = (rank < 6) ? 1 : 0; rkm[ri * 64 + lane] = (unsigned char)rank; wtm[ri * 64 + lane] = wsel / tot * 2.5f; }
        __syncthreads();
    }
    const int nrows = gi * 16;
    if (wave == 0) { unsigned n = 0;
        for (int r = 0; r < nrows; ++r) n += selm[r * 64 + lane];
        unsigned base = 0; if (n && !(PROBE_NOATOM && cnt_shift)) base = __hip_atomic_fetch_add(cnt + 64 * lane, n, __ATOMIC_RELAXED, __HIP_MEMORY_SCOPE_AGENT);
        basem[lane] = base; }
    __syncthreads();
    for (int ri = wave; ri < nrows; ri += 8) { unsigned pos = basem[lane];
        for (int r = 0; r < ri; ++r) pos += selm[r * 64 + lane];
        if (selm[ri * 64 + lane]) { const size_t m = (size_t)(wg + (ri >> 4) * G) * 16 + (ri & 15); const int rk = rkm[ri * 64 + lane];
            LIST[lane * T + pos] = (int)m; WL[lane * T + pos] = wtm[ri * 64 + lane]; SLOT[m * 8 + rk] = ((unsigned)lane << 16) | pos; } }
    __syncthreads();
}
__device__ __forceinline__ void phase_combine_ln2(const Params& p, int l, void* dst, bool dbf, int gw, int NGW, int lane) {
    const bf16* X1 = (const bf16*)(p.ws + WS_X1); const bf16* YE = (const bf16*)(p.ws + WS_YEXP); const unsigned* SLOT = (const unsigned*)(p.ws + WS_SLOT);
    const unsigned* cnt = (const unsigned*)(p.ws + WS_CTL) + CW_CNT + l * 4096;
    const float* g2 = p.in[I_LN2G] + (size_t)l * D; const float* b2 = p.in[I_LN2B] + (size_t)l * D;
    const int tiles = ((int)cnt[64 * lane] + 255) >> 8; const float incl = wave_scan_incl((float)tiles);
    const int toff = (int)incl - tiles;
    const int tsh = __builtin_amdgcn_readlane((int)incl, 63);
    for (int m = gw; m < T; m += NGW) {
        v4f v[8];
#pragma unroll
        for (int j = 0; j < 8; ++j) v[j] = ld4(X1, (size_t)m * D + 4 * lane + 256 * j, true) * ALPHA;
#pragma unroll
        for (int k = 0; k < 7; ++k) { size_t row;
            if (k == 0) row = (size_t)tsh * 256 + m;
            else { const unsigned s = __builtin_amdgcn_readfirstlane(SLOT[(size_t)m * 8 + (k - 1)]); const int e = (int)(s >> 16); row = (size_t)__builtin_amdgcn_readlane(toff, e) * 256 + (s & 0xffffu); }
#if YEXP_FP8
            const unsigned* yr = (const unsigned*)((const unsigned char*)YE + row * D) + lane;
#pragma unroll
            for (int j = 0; j < 8; ++j) { const unsigned y = yr[64 * j]; const auto lo = __builtin_amdgcn_cvt_pk_f32_fp8(y, false), hi = __builtin_amdgcn_cvt_pk_f32_fp8(y, true);
                v[j].x += lo[0] * (1.f / YSC); v[j].y += lo[1] * (1.f / YSC); v[j].z += hi[0] * (1.f / YSC); v[j].w += hi[1] * (1.f / YSC); } }
#else
            const v2u* yr = (const v2u*)(YE + row * D) + lane;
#pragma unroll
            for (int j = 0; j < 8; ++j) { const v2u y = yr[64 * j]; v[j].x += bflo(y.x); v[j].y += bfhi(y.x); v[j].z += bflo(y.y); v[j].w += bfhi(y.y); } }
#endif
        float s = 0.f;
#pragma unroll
        for (int j = 0; j < 8; ++j) s += (v[j].x + v[j].y) + (v[j].z + v[j].w);
        const float mean = wave_sum(s) * (1.f / D); float s2 = 0.f;
#pragma unroll
        for (int j = 0; j < 8; ++j) { v[j] = v[j] - mean; s2 += (v[j].x * v[j].x + v[j].y * v[j].y) + (v[j].z * v[j].z + v[j].w * v[j].w); }
        const float rstd = rsqrtf(wave_sum(s2) * (1.f / D) + LN_EPS);
#pragma unroll
        for (int j = 0; j < 8; ++j) { const v4f gg = ((const v4f*)g2)[lane + 64 * j], bb = ((const v4f*)b2)[lane + 64 * j]; const v4f o = v[j] * rstd * gg + bb;
            if (dbf) ((v2u*)((bf16*)dst + (size_t)m * D))[lane + 64 * j] = (v2u){pk2(o.x, o.y), pk2(o.z, o.w)};
            else ((v4f*)((float*)dst + (size_t)m * D))[lane + 64 * j] = o; }
    }
}

constexpr int NPH = 11;
template <class S> struct DupOrder {
    S s; int n;
    __device__ __forceinline__ bool next(int i, Unit& u) const { return s.next(i >= n ? i - n : i, u); }
    __device__ __forceinline__ int row_token(int i, int r) const { return s.row_token(i >= n ? i - n : i, r); }
    __device__ __forceinline__ void a_ready(const Unit& u) const { s.a_ready(u); }
    __device__ __forceinline__ void done(const Unit& u) const { s.done(u); }
};
template <class S> __device__ __forceinline__ int count_units(const S& s) { Unit u; int n = 0; while (n < 64 && s.next(n, u)) ++n; return n; }
#define ORDER_T(k, T) typename std::conditional<PROBE_DUP == (k), DupOrder<T>, T>::type
template <class S> __device__ __forceinline__ DupOrder<S> make_order(const S& s, std::true_type) { DupOrder<S> d{s, count_units(s)}; d.n = count_units(s); return d; }
template <class S> __device__ __forceinline__ S make_order(const S& s, std::false_type) { return s; }
#define MAKE_ORDER(k, s) make_order(s, std::integral_constant<bool, PROBE_DUP == (k)>())
template <int l>
__device__ __forceinline__ void run_layer(const Params& p, LAS unsigned char* lds, const XcdBarrier& bar, int tid, int lane, int wave, int G, int wg, int gw, int NGW) {
    unsigned char* ws = p.ws;
    {
        const void* xin = (l == 0) ? (const void*)p.in[I_X] : (const void*)(ws + WS_XCUR);
        void* xout = (l == NL - 1) ? (void*)p.out : (void*)(ws + WS_XCUR);
#ifndef PROBE_DUP
#define PROBE_DUP (-1)
#endif
#define IS_GEMM_PH(k) ((k) == 1 || (k) == 5 || (k) == 6 || (k) == 8 || (k) == 9)
#define REP(k) _Pragma("nounroll") for (int _r = 0; _r < ((PROBE_DUP == (k) && !IS_GEMM_PH(k)) ? 2 + (p.ph_lo >> 20) : 1); ++_r)
#ifndef PH_MASK
#define PH_MASK 0x7ff
#endif
#define RUN(k) (((PH_MASK >> (k)) & 1) && p.ph_lo <= l * NPH + (k) && l * NPH + (k) < p.ph_hi)
#define SEAM(k) do { if (l * NPH + (k) + 1 < p.ph_hi) xcd_barrier(bar); } while (0)
        if (RUN(0)) { REP(0) { phase_convert<0>(p, l, lds, gw, NGW, wave, lane);
#if defined(PROBE_CONV0)
            phase_convert<1>(p, l, lds, gw, NGW, wave, lane);
#endif
 phase_xprep(p, l, xin, l > 0, lds, gw, NGW, tid, lane); } SEAM(0); }
        if (RUN(1)) { REP(1) { pg8::Gemm g{(const bf16*)(ws + WS_XB), (const bf16*)(ws + WS_WIN), T, ZC, D / 2, D / 2, D / 2}; pg8::StaticOrder S; S.init(T, (GATE_SPLIT && G == 256) ? ZC_GATE : ZC, G, wg);
            pg8::EpiBf16<0> E{(bf16*)(ws + WS_Z), ZC, nullptr, 0, 0, 1.f / 64.f};
            auto S2 = MAKE_ORDER(1, S); pg8::gemm_phase<pg8::EpiBf16<0>, ORDER_T(1, pg8::StaticOrder), true, true, true>(lds, g, S2, E); } SEAM(1); }
        if (RUN(2)) { REP(2) { for (int it = wg; it < 1536; it += G) { if (it < 512) gdn_pre_item(p, l, lds, it, tid, wave, lane); else if (it < 1024) ml_pre_item(p, l, lds, it - 512, tid, wave, lane); else vt_item(p, lds, it - 1024, tid); } } SEAM(2); }
        if (RUN(3)) { REP(3) { phase_mixers(p, l, lds, wg, G, tid, wave, lane, bar); } SEAM(3); }
        if (RUN(4)) { REP(4) { phase_post(p, l, gw, NGW, lane); } SEAM(4); }
        if (RUN(5)) { REP(5) { constexpr int KM = MERGE_FP8 ? BRW / 2 : BRW; pg8::Gemm g{(const bf16*)(ws + WS_BR), (const bf16*)(ws + WS_WBR), T, D, KM, KM, KM}; pg8::StaticOrder S; S.init(T, D, G, wg);
            EpiMergeH E{(const bf16*)(ws + ((GATE_FP8 && GATE_SPLIT && G == 256) ? WS_MTMP : WS_Z)), (bf16*)(ws + WS_MSUM)};
            auto S2 = MAKE_ORDER(5, S); pg8::gemm_phase<EpiMergeH, ORDER_T(5, pg8::StaticOrder), true, true, MERGE_FP8 != 0>(lds, g, S2, E); } SEAM(5); }
        if (RUN(6)) { REP(6) { pg8::Gemm g{(const bf16*)(ws + WS_MSUM), (const bf16*)(ws + WS_WOUT), T, D, D / 2, D / 2, D / 2}; pg8::StaticOrder S; S.init(T, D, G, wg);
            EpiResid E{xin, (bf16*)(ws + WS_Y), 1.f / 64.f, l > 0};
            auto S2 = MAKE_ORDER(6, S); pg8::gemm_phase<EpiResid, ORDER_T(6, pg8::StaticOrder), true, true, true>(lds, g, S2, E); } SEAM(6); }
        if (RUN(7)) { REP(7) { phase_ln1_router(p, l, lds, wg, G, wave, lane, (PROBE_DUP == 7 && _r == 0) ? 16384 : 0); } SEAM(7); }
        if (RUN(8)) { REP(8) { const unsigned* cnt = (const unsigned*)(ws + WS_CTL) + CW_CNT + l * 4096; MoeTab M(lds); moe_tables(M, cnt, tid, lane, wave);
            UpOrder S{M, 0}; S.n = up_order_build(M, (const int*)(ws + WS_LIST), (const float*)(ws + WS_WL), wg, G, tid);
            constexpr int KU = MOE_UP_FP8 ? D / 2 : D;
            pg8::Gemm g{(const bf16*)(ws + WS_X1B), (const bf16*)(ws + WS_WUP), T, NEX * 1024, KU, KU, KU};
            EpiGluSparse E{(LAS const float*)M.wt, (bf16*)(ws + WS_HB)};
            auto S2 = MAKE_ORDER(8, S); pg8::gemm_phase_gather<EpiGluSparse, ORDER_T(8, UpOrder), MOE_UP_FP8 != 0>(lds, g, S2, E); } SEAM(8); }
        if (RUN(9)) { REP(9) { const unsigned* cnt = (const unsigned*)(ws + WS_CTL) + CW_CNT + l * 4096; MoeTab M(lds); moe_tables(M, cnt, tid, lane, wave);
            DownOrder S{M, G, wg, 8 * M.t[65]};
            constexpr int KD = MOE_DN_FP8 ? ED / 2 : ED;
            pg8::Gemm g{(const bf16*)(ws + WS_HB), (const bf16*)(ws + WS_WDN), HROWS, NEX * D, KD, KD, KD};
            EpiYexp E{(bf16*)(ws + WS_YEXP)};
            auto S2 = MAKE_ORDER(9, S); pg8::gemm_phase<EpiYexp, ORDER_T(9, DownOrder), true, true, MOE_DN_FP8 != 0>(lds, g, S2, E); } SEAM(9); }
        if (RUN(10)) { REP(10) { phase_combine_ln2(p, l, xout, l != NL - 1, gw, NGW, lane); } SEAM(10); }
#undef RUN
#undef SEAM
    }
}
__global__ void __launch_bounds__(512, 2) fwd_kernel(Params p) {
    extern __shared__ __attribute__((aligned(16))) unsigned char lds_raw[];
    LAS unsigned char* lds = (LAS unsigned char*)lds_raw;
    const int tid = threadIdx.x, lane = tid & 63, wave = __builtin_amdgcn_readfirstlane(tid >> 6);
    const int G = gridDim.x, wg = blockIdx.x, gw = wg * 8 + wave, NGW = G * 8;
    volatile LAS unsigned* MISC = (volatile LAS unsigned*)(lds + MISC_OFF);
    if (tid < 32) MISC[tid] = 0u;
    __syncthreads();
    unsigned* ctl = (unsigned*)(p.ws + WS_CTL);
    const bool multi = (p.ph_hi - p.ph_lo) > 1;
    XcdBarrier bar; bar.bar = ctl + CW_BAR; bar.x = 0; bar.st = nullptr;
    if (multi) bar = xcd_barrier_post(ctl + CW_BAR, MISC + 8);
    run_layer<0>(p, lds, bar, tid, lane, wave, G, wg, gw, NGW);
    run_layer<1>(p, lds, bar, tid, lane, wave, G, wg, gw, NGW);
}

#ifndef MK_MULTI_LAUNCH
#define MK_MULTI_LAUNCH 0
#endif
extern "C" void kernel_launch(void* const* d_in, const int* in_sizes, int n_in, void* d_out, int out_size, void* d_ws, size_t ws_size, hipStream_t stream) {
    static int grid = 0;
    if (grid == 0) {
        if (n_in != 27 || out_size != T * D || ws_size < WS_END) { fprintf(stderr, "kernel_launch: unexpected shapes (n_in %d out %d ws %zu need %zu)\n", n_in, out_size, ws_size, (size_t)WS_END); grid = -1; return; }
        int dev = 0, cus = 0, per_cu = 0;
        if (hipGetDevice(&dev) != hipSuccess || hipDeviceGetAttribute(&cus, hipDeviceAttributeMultiprocessorCount, dev) != hipSuccess) { grid = -1; return; }
        if (hipFuncSetAttribute((const void*)fwd_kernel, hipFuncAttributeMaxDynamicSharedMemorySize, LDS_BYTES) != hipSuccess) { fprintf(stderr, "kernel_launch: hipFuncSetAttribute failed\n"); grid = -1; return; }
        if (hipOccupancyMaxActiveBlocksPerMultiprocessor(&per_cu, (const void*)fwd_kernel, 512, LDS_BYTES) != hipSuccess || per_cu < 1) { fprintf(stderr, "kernel_launch: occupancy query says %d\n", per_cu); }
        (void)hipGetLastError();
        grid = cus;
        if (GATE_FP8 && GATE_SPLIT && cus != 256) { fprintf(stderr, "kernel_launch: this build's phase-3 role split assumes 256 CUs (have %d)\n", cus); grid = -1; return; }
    }
    if (grid < 0) return;
    (void)hipMemsetAsync((char*)d_ws + WS_CTL, 0, CTL_ZERO_BYTES, stream);
    Params p{};
    for (int i = 0; i < 27; ++i) p.in[i] = (const float*)d_in[i];
    p.out = (float*)d_out; p.ws = (unsigned char*)d_ws;
#if MK_MULTI_LAUNCH
    for (int ph = 0; ph < NL * NPH; ++ph) { p.ph_lo = ph; p.ph_hi = ph + 1; hipLaunchKernelGGL(fwd_kernel, dim3(grid), dim3(512), LDS_BYTES, stream, p); }
#else
    p.ph_lo = 0; p.ph_hi = NL * NPH; hipLaunchKernelGGL(fwd_kernel, dim3(grid), dim3(512), LDS_BYTES, stream, p);
#endif
}
```

```cpp
#include <hip/hip_runtime.h>
#include <cstdio>
#include <cstdint>
#include <type_traits>
namespace pg8 {
#define PG8_LAS __attribute__((address_space(3)))
typedef unsigned short bf16_t;
typedef short bf16x8 __attribute__((ext_vector_type(8)));
typedef float f32x4 __attribute__((ext_vector_type(4)));
typedef unsigned u32x4 __attribute__((ext_vector_type(4)));
constexpr int BM = 256, BK = 64, HALF = 128, HTB = HALF * BK * 2  , STAGE_BYTES = 8 * HTB, NXCD = 8, WGM = 8;

__host__ __device__ __forceinline__ int lds_byte(int r, int c) { const int st = (r >> 4) * 2 + (c >> 5), rr = r & 15, cc = c & 31, ob = rr * 64 + cc * 2; return st * 1024 + (ob ^ (((ob >> 9) & 1) << 5)); }
__host__ __device__ __forceinline__ void stage_rc(int b, int& R, int& C) { const int st = b / 1024, sb = b % 1024, swz = sb ^ (((sb >> 9) & 1) << 5); R = (st >> 1) * 16 + swz / 64; C = (st & 1) * 32 + (swz % 64) / 2; }
__host__ __device__ __forceinline__ int perm32(int rho) { const int n = rho >> 4, i = rho & 15; return 8 * (i >> 2) + 4 * n + (i & 3); }

struct Unit { int pm, pn, aux; };
struct Gemm { const bf16_t* A; const bf16_t* Bt; int M, N, K, lda, ldb; };

struct StaticOrder {
    int nM, nN, nwg, G, c;
    __host__ __device__ void init(int M, int N, int G_, int c_) { nM = M / BM; nN = N / BM; nwg = nM * nN; G = G_; c = c_; }
    __host__ __device__ bool next(int i, Unit& u) const {
        const long L = (long)i * G + c; if (L >= nwg) return false;
        int wgid = (int)L; { const int q = nwg / NXCD, r = nwg % NXCD, xcd = wgid % NXCD, off = wgid / NXCD; wgid = (xcd < r ? xcd * (q + 1) : r * (q + 1) + (xcd - r) * q) + off; }
        const int nig = WGM * nN, gid = wgid / nig, fm = gid * WGM, gsz = (nM - fm) < WGM ? (nM - fm) : WGM;
        u.pm = fm + ((wgid % nig) % gsz); u.pn = (wgid % nig) / gsz; return true;
    }
    __device__ __forceinline__ void a_ready(const Unit&) const {}
    __device__ __forceinline__ void done(const Unit&) const {}
};

__device__ __forceinline__ unsigned cvt_pk_bf16(float lo, float hi) { unsigned r; asm volatile("v_cvt_pk_bf16_f32 %0, %1, %2" : "=v"(r) : "v"(lo), "v"(hi)); return r; }
typedef float f32x2 __attribute__((ext_vector_type(2)));
__device__ __forceinline__ f32x2 gelu_pk(f32x2 v) {
    const f32x2 av = __builtin_elementwise_abs(v), d = av * 0.2316418882f + 1.0f;
    f32x2 t; t.x = __builtin_amdgcn_rcpf(d.x); t.y = __builtin_amdgcn_rcpf(d.y);
    f32x2 q = t * 0.5307027145f + (-0.7265760135f); q = q * t + 0.7107068705f; q = q * t + (-0.142248368f); q = q * t + 0.127414796f; q = q * t;
    const f32x2 s = (v * v) * (-0.72134752044f);
    f32x2 e; e.x = __builtin_amdgcn_exp2f(s.x); e.y = __builtin_amdgcn_exp2f(s.y);
    const f32x2 m = v * (q * e), r = v - m;
    f32x2 o; o.x = v.x < 0.f ? m.x : r.x; o.y = v.y < 0.f ? m.y : r.y; return o;
}

template <int ACT  > struct EpiBf16 {
    static constexpr bool PERM = true, AFTER_DRAIN = false; static constexpr int MID = 0; static_assert(ACT == 0 || ACT == 1, "EpiBf16: ACT is 0 (none) or 1 (gelu_pk)");
    bf16_t* O; int ldc; const float* bias; int split_cols; size_t split_stride; float scale0;
    __device__ __forceinline__ void operator()(const f32x4 (&acc)[2][2][4][2], const Unit& u, int wr, int wc, int fr, int fq) const {
        const int row0 = u.pm * BM + wr * 64 + fr; int colt = u.pn * BM; bf16_t* base = O;
        float sc = scale0; if (split_cols) { const int t = colt / split_cols; base += (size_t)t * split_stride; colt -= t * split_cols; if (t != 0) sc = 1.f; }
        const int col0 = colt + wc * 32 + 8 * fq, bcol0 = u.pn * BM + wc * 32 + 8 * fq;
        f32x4 bv[2][2];
#pragma unroll
        for (int bj = 0; bj < 2; ++bj)
#pragma unroll
            for (int n = 0; n < 2; ++n) bv[bj][n] = bias ? *(const f32x4*)(bias + bcol0 + bj * HALF + 4 * n) : (f32x4){0.f, 0.f, 0.f, 0.f};
#pragma unroll
        for (int ai = 0; ai < 2; ++ai)
#pragma unroll
            for (int m = 0; m < 4; ++m) { bf16_t* rowp = base + (size_t)(row0 + ai * HALF + m * 16) * ldc + col0;
#pragma unroll
                for (int bj = 0; bj < 2; ++bj) { f32x4 v0 = acc[ai][bj][m][0] + bv[bj][0], v1 = acc[ai][bj][m][1] + bv[bj][1];
                    if (ACT == 1) { f32x2 a = gelu_pk((f32x2){v0[0], v0[1]}), b = gelu_pk((f32x2){v0[2], v0[3]}), c = gelu_pk((f32x2){v1[0], v1[1]}), d = gelu_pk((f32x2){v1[2], v1[3]});
                        v0 = (f32x4){a.x, a.y, b.x, b.y}; v1 = (f32x4){c.x, c.y, d.x, d.y}; }
                    v0 = v0 * sc; v1 = v1 * sc; u32x4 w; w.x = cvt_pk_bf16(v0[0], v0[1]); w.y = cvt_pk_bf16(v0[2], v0[3]); w.z = cvt_pk_bf16(v1[0], v1[1]); w.w = cvt_pk_bf16(v1[2], v1[3]);
                    *(u32x4*)(rowp + bj * HALF) = w; } }
    }
};

typedef int i32x8 __attribute__((ext_vector_type(8)));
__device__ __forceinline__ i32x8 cat8(const bf16x8 a, const bf16x8 b) { typedef int i32x4 __attribute__((ext_vector_type(4))); const i32x4 x = __builtin_bit_cast(i32x4, a), y = __builtin_bit_cast(i32x4, b); return (i32x8){x[0], x[1], x[2], x[3], y[0], y[1], y[2], y[3]}; }
__device__ __forceinline__ bf16x8 lo8(const i32x8 v) { typedef int i32x4 __attribute__((ext_vector_type(4))); return __builtin_bit_cast(bf16x8, __builtin_shufflevector(v, v, 0, 1, 2, 3)); }
__device__ __forceinline__ bf16x8 hi8(const i32x8 v) { typedef int i32x4 __attribute__((ext_vector_type(4))); return __builtin_bit_cast(bf16x8, __builtin_shufflevector(v, v, 4, 5, 6, 7)); }
template <class Epi, class Sched, bool ALIGN_EPI = false, bool SP2 = false, bool FP8 = false>
__device__ __forceinline__ void gemm_phase(PG8_LAS unsigned char* lds, const Gemm g, const Sched& S, const Epi& E) {
    const int tid = threadIdx.x, wid = __builtin_amdgcn_readfirstlane(tid >> 6), lane = tid & 63, wr = wid >> 2, wc = wid & 3, fr = lane & 15, fq = lane >> 4;
    const int K = g.K, nt = K / BK;
    unsigned voffA[2], voffB[2];
#pragma unroll
    for (int i = 0; i < 2; ++i) { int R, C; stage_rc(tid * 16 + i * 8192, R, C); const int Rb = Epi::PERM ? ((R & ~31) + perm32(R & 31)) : R;
        voffA[i] = (unsigned)(R * g.lda + C) * 2u; voffB[i] = (unsigned)(Rb * g.ldb + C) * 2u; }
    const size_t kstep = (size_t)(BK * 2);
    const size_t hstepA = (size_t)HALF * g.lda * 2, hstepB = (size_t)HALF * g.ldb * 2;
    const size_t tstepA = 2 * hstepA, tstepB = 2 * hstepB;
    const unsigned ldsw = (unsigned)wid * 1024u;
    const int aoff = lds_byte(wr * 64 + fr, fq * 8), boff = lds_byte(wc * 32 + fr, fq * 8);
#define PG8_SA(b, h) (((b) * 2 + (h)) * HTB)
#define PG8_SB(b, h) ((4 + (b) * 2 + (h)) * HTB)
#define PG8_STAGE(bufoff, gbase, voff) do { _Pragma("unroll") for (int _i = 0; _i < 2; ++_i) \
        __builtin_amdgcn_global_load_lds((const unsigned*)((const char*)(gbase) + (voff)[_i]), (PG8_LAS unsigned*)(lds + (bufoff) + ldsw + _i * 8192), 16, 0, 0); } while (0)
#define PG8_LDA(dst, b, h) do { _Pragma("unroll") for (int m = 0; m < 4; ++m) { if constexpr (FP8) dst##8[m] = cat8(*(const PG8_LAS bf16x8*)(lds + PG8_SA(b, h) + aoff + m * 2048), *(const PG8_LAS bf16x8*)(lds + PG8_SA(b, h) + aoff + m * 2048 + 1024)); \
        else { _Pragma("unroll") for (int k = 0; k < 2; ++k) dst[m][k] = *(const PG8_LAS bf16x8*)(lds + PG8_SA(b, h) + aoff + m * 2048 + k * 1024); } } } while (0)
#define PG8_LDB(dst, b, h) do { _Pragma("unroll") for (int n = 0; n < 2; ++n) { if constexpr (FP8) dst##8[n] = cat8(*(const PG8_LAS bf16x8*)(lds + PG8_SB(b, h) + boff + n * 2048), *(const PG8_LAS bf16x8*)(lds + PG8_SB(b, h) + boff + n * 2048 + 1024)); \
        else { _Pragma("unroll") for (int k = 0; k < 2; ++k) dst[n][k] = *(const PG8_LAS bf16x8*)(lds + PG8_SB(b, h) + boff + n * 2048 + k * 1024); } } } while (0)
#define PG8_MMA(ai, bj, At, Bt) do { __builtin_amdgcn_s_setprio(1); _Pragma("unroll") for (int m = 0; m < 4; ++m) _Pragma("unroll") for (int n = 0; n < 2; ++n) { \
        if constexpr (FP8) asm volatile("v_mfma_scale_f32_16x16x128_f8f6f4 %0, %1, %2, %0, %3, %3 op_sel_hi:[0,0,0]" : "+v"(acc[ai][bj][m][n]) : "v"(Bt##8[n]), "v"(At##8[m]), "v"(fp8_unit_scale)); \
        else { _Pragma("unroll") for (int k = 0; k < 2; ++k) acc[ai][bj][m][n] = __builtin_amdgcn_mfma_f32_16x16x32_bf16(Bt[n][k], At[m][k], acc[ai][bj][m][n], 0, 0, 0); } } __builtin_amdgcn_s_setprio(0); } while (0)
#define PG8_WAIT_V(n) asm volatile("s_waitcnt vmcnt(" #n ")" ::: "memory")
#define PG8_WAIT_L(n) asm volatile("s_waitcnt lgkmcnt(" #n ")" ::: "memory")
#define PG8_BAR __builtin_amdgcn_s_barrier()
#define PG8_SCHED __builtin_amdgcn_sched_barrier(0)
    Unit cur, nxt; int ui = 0;
    if (!S.next(0, cur)) return;
    f32x4 acc[2][2][4][2];
#pragma unroll
    for (int a = 0; a < 2; ++a)
#pragma unroll
        for (int b = 0; b < 2; ++b)
#pragma unroll
            for (int m = 0; m < 4; ++m)
#pragma unroll
                for (int n = 0; n < 2; ++n) acc[a][b][m][n] = (f32x4){0.f, 0.f, 0.f, 0.f};
    int fp8_unit_scale = 0x7F7F7F7F; asm volatile("" : "+v"(fp8_unit_scale));
    bf16x8 At[4][2], B0[2][2], B1[2][2];
    i32x8 At8[4], B08[2], B18[2];
    const char* cA = (const char*)g.A + (size_t)cur.pm * tstepA; const char* cB = (const char*)g.Bt + (size_t)cur.pn * tstepB;
    S.a_ready(cur);
    if constexpr (SP2) {
        PG8_STAGE(PG8_SB(0, 0), cB, voffB); PG8_STAGE(PG8_SB(0, 1), cB + hstepB, voffB); PG8_STAGE(PG8_SA(0, 0), cA, voffA); PG8_STAGE(PG8_SA(0, 1), cA + hstepA, voffA);
        if (wr == 1) PG8_BAR;
        PG8_WAIT_V(2); PG8_BAR;
        PG8_STAGE(PG8_SB(1, 0), cB + kstep, voffB); PG8_STAGE(PG8_SA(1, 0), cA + kstep, voffA); PG8_STAGE(PG8_SB(1, 1), cB + hstepB + kstep, voffB);
        PG8_WAIT_V(6); PG8_BAR;
    } else {
        PG8_STAGE(PG8_SB(0, 0), cB, voffB); PG8_STAGE(PG8_SA(0, 0), cA, voffA); PG8_STAGE(PG8_SB(0, 1), cB + hstepB, voffB); PG8_STAGE(PG8_SA(0, 1), cA + hstepA, voffA);
        if (wr == 1) PG8_BAR;
        PG8_WAIT_V(4); PG8_BAR;
        PG8_STAGE(PG8_SB(1, 0), cB + kstep, voffB); PG8_STAGE(PG8_SA(1, 0), cA + kstep, voffA); PG8_STAGE(PG8_SB(1, 1), cB + hstepB + kstep, voffB);
        PG8_WAIT_V(6); PG8_BAR;
    }
    for (;;) {
        const bool has_next = S.next(ui + 1, nxt);
        const char* nA = has_next ? (const char*)g.A + (size_t)nxt.pm * tstepA : cA; const char* nB = has_next ? (const char*)g.Bt + (size_t)nxt.pn * tstepB : cB;
        for (int t = 0; t < nt; t += 2) {
            const bool last = (t == nt - 2);
            const char* a1 = cA + (size_t)(t + 1) * kstep;
            const char* a2 = last ? nA : cA + (size_t)(t + 2) * kstep; const char* b2 = last ? nB : cB + (size_t)(t + 2) * kstep;
            const char* a3 = a2 + kstep; const char* b3 = b2 + kstep;
            if (last && has_next) S.a_ready(nxt);
            if constexpr (SP2) {
            if constexpr (Epi::MID > 0) { if (t != 0 && (t % Epi::MID) == 0) { PG8_SCHED; if constexpr (FP8) asm volatile("s_nop 7\n\ts_nop 7" ::: "memory"); E.mid(acc, cur, t / Epi::MID, wr, wc, fr, fq); if constexpr (FP8) asm volatile("s_nop 7" ::: "memory"); PG8_SCHED; } }
            PG8_LDB(B0, 0, 0); PG8_LDB(B1, 0, 1); PG8_SCHED; PG8_LDA(At, 0, 0); PG8_STAGE(PG8_SA(1, 1), a1 + hstepA, voffA);
            PG8_WAIT_V(8); PG8_WAIT_L(0); PG8_BAR; PG8_MMA(0, 0, At, B0); PG8_MMA(0, 1, At, B1); PG8_BAR; PG8_SCHED;
            PG8_LDA(At, 0, 1); PG8_STAGE(PG8_SB(0, 0), b2, voffB); PG8_STAGE(PG8_SB(0, 1), b2 + hstepB, voffB); PG8_STAGE(PG8_SA(0, 0), a2, voffA);
            PG8_WAIT_V(8); PG8_WAIT_L(0); PG8_BAR; PG8_MMA(1, 0, At, B0); PG8_MMA(1, 1, At, B1); PG8_BAR; PG8_SCHED;
            PG8_LDB(B0, 1, 0); PG8_LDB(B1, 1, 1); PG8_SCHED; PG8_LDA(At, 1, 0); PG8_STAGE(PG8_SA(0, 1), a2 + hstepA, voffA);
            PG8_WAIT_V(8); PG8_WAIT_L(0); PG8_BAR; PG8_MMA(0, 0, At, B0); PG8_MMA(0, 1, At, B1); PG8_BAR; PG8_SCHED;
            PG8_LDA(At, 1, 1); PG8_STAGE(PG8_SB(1, 0), b3, voffB); PG8_STAGE(PG8_SB(1, 1), b3 + hstepB, voffB); PG8_STAGE(PG8_SA(1, 0), a3, voffA);
            PG8_WAIT_V(8); PG8_WAIT_L(0); PG8_BAR; PG8_MMA(1, 0, At, B0); PG8_MMA(1, 1, At, B1); PG8_BAR; PG8_SCHED;
            } else {
            PG8_LDB(B0, 0, 0); PG8_SCHED; PG8_LDA(At, 0, 0); PG8_STAGE(PG8_SA(1, 1), a1 + hstepA, voffA);
            PG8_WAIT_L(8); PG8_BAR; PG8_WAIT_L(0); PG8_MMA(0, 0, At, B0); PG8_BAR; PG8_SCHED;
            PG8_LDB(B1, 0, 1); PG8_STAGE(PG8_SB(0, 0), b2, voffB);
            PG8_BAR; PG8_WAIT_L(0); PG8_MMA(0, 1, At, B1); PG8_BAR;
            PG8_LDA(At, 0, 1); PG8_STAGE(PG8_SA(0, 0), a2, voffA);
            PG8_BAR; PG8_WAIT_L(0); PG8_MMA(1, 0, At, B0); PG8_BAR; PG8_SCHED;
            PG8_STAGE(PG8_SB(0, 1), b2 + hstepB, voffB);
            PG8_WAIT_V(6); PG8_BAR; PG8_MMA(1, 1, At, B1); PG8_BAR;
            PG8_LDB(B0, 1, 0); PG8_SCHED; PG8_LDA(At, 1, 0); PG8_STAGE(PG8_SA(0, 1), a2 + hstepA, voffA);
            PG8_WAIT_L(8); PG8_BAR; PG8_WAIT_L(0); PG8_MMA(0, 0, At, B0); PG8_BAR; PG8_SCHED;
            PG8_LDB(B1, 1, 1); PG8_STAGE(PG8_SB(1, 0), b3, voffB);
            PG8_BAR; PG8_WAIT_L(0); PG8_MMA(0, 1, At, B1); PG8_BAR;
            PG8_LDA(At, 1, 1); PG8_STAGE(PG8_SA(1, 0), a3, voffA);
            PG8_BAR; PG8_WAIT_L(0); PG8_MMA(1, 0, At, B0); PG8_BAR; PG8_SCHED;
            PG8_STAGE(PG8_SB(1, 1), b3 + hstepB, voffB);
            PG8_WAIT_V(6); PG8_BAR; PG8_MMA(1, 1, At, B1); PG8_BAR;
            }
        }
        if constexpr (ALIGN_EPI) { if (wr == 0) PG8_BAR; }
        if constexpr (FP8) asm volatile("s_nop 7\n\ts_nop 7" ::: "memory");
        if constexpr (!Epi::AFTER_DRAIN) { E(acc, cur, wr, wc, fr, fq); S.done(cur); }
        if (!has_next) break;
#pragma unroll
        for (int a = 0; a < 2; ++a)
#pragma unroll
            for (int b = 0; b < 2; ++b)
#pragma unroll
                for (int m = 0; m < 4; ++m)
#pragma unroll
                    for (int n = 0; n < 2; ++n) acc[a][b][m][n] = (f32x4){0.f, 0.f, 0.f, 0.f};
        cur = nxt; cA = nA; cB = nB; ++ui;
        if constexpr (ALIGN_EPI) { if (wr == 1) PG8_BAR; }
    }
    PG8_WAIT_V(0);
    if constexpr (!ALIGN_EPI) { if (wr == 0) PG8_BAR; }
    PG8_BAR;
    if constexpr (Epi::AFTER_DRAIN) { E.fused(acc, cur, wr, wc, fr, fq, lds, wid, lane); S.done(cur); }
#undef PG8_SA
#undef PG8_SB
#undef PG8_STAGE
#undef PG8_LDA
#undef PG8_LDB
#undef PG8_MMA
#undef PG8_WAIT_V
#undef PG8_WAIT_L
#undef PG8_BAR
#undef PG8_SCHED
}
template <class Epi, class Sched, bool FP8 = false>
__device__ __forceinline__ void gemm_phase_gather(PG8_LAS unsigned char* lds, const Gemm g, const Sched& S, const Epi& E) {
    const int tid = threadIdx.x, wid = __builtin_amdgcn_readfirstlane(tid >> 6), lane = tid & 63, wr = wid >> 2, wc = wid & 3, fr = lane & 15, fq = lane >> 4;
    const int K = g.K, nt = K / BK;
    unsigned voffB[2]; int RA[2], CA[2];
#pragma unroll
    for (int i = 0; i < 2; ++i) { int R, C; stage_rc(tid * 16 + i * 8192, R, C); const int Rb = Epi::PERM ? ((R & ~31) + perm32(R & 31)) : R;
        RA[i] = R; CA[i] = C; voffB[i] = (unsigned)(Rb * g.ldb + C) * 2u; }
    const size_t kstep = (size_t)(BK * 2);
    const size_t hstepB = (size_t)HALF * g.ldb * 2, tstepB = 2 * hstepB;
    const unsigned ldsw = (unsigned)wid * 1024u;
    const int aoff = lds_byte(wr * 64 + fr, fq * 8), boff = lds_byte(wc * 32 + fr, fq * 8);
#define PG8_SA(b, h) (((b) * 2 + (h)) * HTB)
#define PG8_SB(b, h) ((4 + (b) * 2 + (h)) * HTB)
#define PG8_STAGE(bufoff, gbase, voff) do { _Pragma("unroll") for (int _i = 0; _i < 2; ++_i) \
        __builtin_amdgcn_global_load_lds((const unsigned*)((const char*)(gbase) + (voff)[_i]), (PG8_LAS unsigned*)(lds + (bufoff) + ldsw + _i * 8192), 16, 0, 0); } while (0)
#define PG8_LDA(dst, b, h) do { _Pragma("unroll") for (int m = 0; m < 4; ++m) { if constexpr (FP8) dst##8[m] = cat8(*(const PG8_LAS bf16x8*)(lds + PG8_SA(b, h) + aoff + m * 2048), *(const PG8_LAS bf16x8*)(lds + PG8_SA(b, h) + aoff + m * 2048 + 1024)); \
        else { _Pragma("unroll") for (int k = 0; k < 2; ++k) dst[m][k] = *(const PG8_LAS bf16x8*)(lds + PG8_SA(b, h) + aoff + m * 2048 + k * 1024); } } } while (0)
#define PG8_LDB(dst, b, h) do { _Pragma("unroll") for (int n = 0; n < 2; ++n) { if constexpr (FP8) dst##8[n] = cat8(*(const PG8_LAS bf16x8*)(lds + PG8_SB(b, h) + boff + n * 2048), *(const PG8_LAS bf16x8*)(lds + PG8_SB(b, h) + boff + n * 2048 + 1024)); \
        else { _Pragma("unroll") for (int k = 0; k < 2; ++k) dst[n][k] = *(const PG8_LAS bf16x8*)(lds + PG8_SB(b, h) + boff + n * 2048 + k * 1024); } } } while (0)
#define PG8_MMA(ai, bj, At, Bt) do { __builtin_amdgcn_s_setprio(1); _Pragma("unroll") for (int m = 0; m < 4; ++m) _Pragma("unroll") for (int n = 0; n < 2; ++n) { \
        if constexpr (FP8) asm volatile("v_mfma_scale_f32_16x16x128_f8f6f4 %0, %1, %2, %0, %3, %3 op_sel_hi:[0,0,0]" : "+v"(acc[ai][bj][m][n]) : "v"(Bt##8[n]), "v"(At##8[m]), "v"(fp8_unit_scale)); \
        else { _Pragma("unroll") for (int k = 0; k < 2; ++k) acc[ai][bj][m][n] = __builtin_amdgcn_mfma_f32_16x16x32_bf16(Bt[n][k], At[m][k], acc[ai][bj][m][n], 0, 0, 0); } } __builtin_amdgcn_s_setprio(0); } while (0)
#define PG8_WAIT_V(n) asm volatile("s_waitcnt vmcnt(" #n ")" ::: "memory")
#define PG8_WAIT_L(n) asm volatile("s_waitcnt lgkmcnt(" #n ")" ::: "memory")
#define PG8_BAR __builtin_amdgcn_s_barrier()
#define PG8_SCHED __builtin_amdgcn_sched_barrier(0)
#define PG8_ROWS(dst, ui_) do { _Pragma("unroll") for (int _h = 0; _h < 2; ++_h) _Pragma("unroll") for (int _i = 0; _i < 2; ++_i) \
        dst[_h][_i] = (unsigned)S.row_token((ui_), _h * HALF + RA[_i]) * (unsigned)(g.lda * 2) + (unsigned)(CA[_i] * 2); } while (0)
    Unit cur, nxt; int ui = 0;
    if (!S.next(0, cur)) return;
    f32x4 acc[2][2][4][2];
#pragma unroll
    for (int a = 0; a < 2; ++a)
#pragma unroll
        for (int b = 0; b < 2; ++b)
#pragma unroll
            for (int m = 0; m < 4; ++m)
#pragma unroll
                for (int n = 0; n < 2; ++n) acc[a][b][m][n] = (f32x4){0.f, 0.f, 0.f, 0.f};
    int fp8_unit_scale = 0x7F7F7F7F; asm volatile("" : "+v"(fp8_unit_scale));
    bf16x8 At[4][2], B0[2][2], B1[2][2];
    i32x8 At8[4], B08[2], B18[2];
    unsigned offC[2][2];
    PG8_ROWS(offC, 0);
    const char* gA = (const char*)g.A;
    const char* cB = (const char*)g.Bt + (size_t)cur.pn * tstepB;
    PG8_STAGE(PG8_SB(0, 0), cB, voffB); PG8_STAGE(PG8_SB(0, 1), cB + hstepB, voffB); PG8_STAGE(PG8_SA(0, 0), gA, offC[0]); PG8_STAGE(PG8_SA(0, 1), gA, offC[1]);
    if (wr == 1) PG8_BAR;
    PG8_WAIT_V(2); PG8_BAR;
    PG8_STAGE(PG8_SB(1, 0), cB + kstep, voffB); PG8_STAGE(PG8_SA(1, 0), gA + kstep, offC[0]); PG8_STAGE(PG8_SB(1, 1), cB + hstepB + kstep, voffB);
    PG8_WAIT_V(6); PG8_BAR;
    for (;;) {
        const bool has_next = S.next(ui + 1, nxt);
        const char* nB = has_next ? (const char*)g.Bt + (size_t)nxt.pn * tstepB : cB;
        for (int t = 0; t < nt; t += 2) {
            const bool last = (t == nt - 2);
            const char* a1 = gA + (size_t)(t + 1) * kstep;
            const char* a2 = last ? gA : gA + (size_t)(t + 2) * kstep; const char* b2 = last ? nB : cB + (size_t)(t + 2) * kstep;
            const char* a3 = a2 + kstep; const char* b3 = b2 + kstep;
            PG8_LDB(B0, 0, 0); PG8_LDB(B1, 0, 1); PG8_SCHED; PG8_LDA(At, 0, 0); PG8_STAGE(PG8_SA(1, 1), a1, offC[1]);
            if (last && has_next) { PG8_ROWS(offC, ui + 1); }
            PG8_WAIT_V(8); PG8_WAIT_L(0); PG8_BAR; PG8_MMA(0, 0, At, B0); PG8_MMA(0, 1, At, B1); PG8_BAR; PG8_SCHED;
            PG8_LDA(At, 0, 1); PG8_STAGE(PG8_SB(0, 0), b2, voffB); PG8_STAGE(PG8_SB(0, 1), b2 + hstepB, voffB); PG8_STAGE(PG8_SA(0, 0), a2, offC[0]);
            PG8_WAIT_V(8); PG8_WAIT_L(0); PG8_BAR; PG8_MMA(1, 0, At, B0); PG8_MMA(1, 1, At, B1); PG8_BAR; PG8_SCHED;
            PG8_LDB(B0, 1, 0); PG8_LDB(B1, 1, 1); PG8_SCHED; PG8_LDA(At, 1, 0); PG8_STAGE(PG8_SA(0, 1), a2, offC[1]);
            PG8_WAIT_V(8); PG8_WAIT_L(0); PG8_BAR; PG8_MMA(0, 0, At, B0); PG8_MMA(0, 1, At, B1); PG8_BAR; PG8_SCHED;
            PG8_LDA(At, 1, 1); PG8_STAGE(PG8_SB(1, 0), b3, voffB); PG8_STAGE(PG8_SB(1, 1), b3 + hstepB, voffB); PG8_STAGE(PG8_SA(1, 0), a3, offC[0]);
            PG8_WAIT_V(8); PG8_WAIT_L(0); PG8_BAR; PG8_MMA(1, 0, At, B0); PG8_MMA(1, 1, At, B1); PG8_BAR; PG8_SCHED;
        }
        if (wr == 0) PG8_BAR;
        if constexpr (FP8) asm volatile("s_nop 7\n\ts_nop 7" ::: "memory");
        E(acc, cur, wr, wc, fr, fq); S.done(cur);
        if (!has_next) break;
#pragma unroll
        for (int a = 0; a < 2; ++a)
#pragma unroll
            for (int b = 0; b < 2; ++b)
#pragma unroll
                for (int m = 0; m < 4; ++m)
#pragma unroll
                    for (int n = 0; n < 2; ++n) acc[a][b][m][n] = (f32x4){0.f, 0.f, 0.f, 0.f};
        cur = nxt; cB = nB; ++ui;
        if (wr == 1) PG8_BAR;
    }
    PG8_WAIT_V(0);
    PG8_BAR;
#undef PG8_ROWS
#undef PG8_SA
#undef PG8_SB
#undef PG8_STAGE
#undef PG8_LDA
#undef PG8_LDB
#undef PG8_MMA
#undef PG8_WAIT_V
#undef PG8_WAIT_L
#undef PG8_BAR
#undef PG8_SCHED
}
}

#ifndef GATE_FP8
#define GATE_FP8 1
#endif
#ifndef GATE_SPLIT
#define GATE_SPLIT 1
#endif
#ifndef YEXP_FP8
#define YEXP_FP8 1
#endif
#ifndef CONV_SKIP
#define CONV_SKIP 6
#endif
#ifndef MERGE_FP8
#define MERGE_FP8 1
#endif
#ifndef MOE_DN_FP8
#define MOE_DN_FP8 1
#endif
#ifndef MOE_UP_FP8
#define MOE_UP_FP8 1
#endif
#ifndef PROBE_NOATOM
#define PROBE_NOATOM 0
#endif
constexpr int T = 8192, D = 2048, NL = 2, BW = 512, ZC = 14336, INC = 14352;
constexpr int NE = 64, NEX = 65  , ED = 512;
constexpr int BRW = 4 * BW;
constexpr int HK = NEX * ED;
constexpr float ALPHA = 1.41421356237f;
constexpr float LN_EPS = 1e-5f;
constexpr float UPSC = MOE_UP_FP8 ? (1.f / 64.f) : 1.f;
constexpr float BRSC = MERGE_FP8 ? 8.f : 1.f, MGSC = MERGE_FP8 ? (1.f / (8.f * 64.f)) : 1.f;
constexpr float GSC = 8.f;
constexpr float YSC = 64.f;
constexpr float HSC = 8.f, DNSC = MOE_DN_FP8 ? (1.f / (HSC * 64.f)) : 1.f;
constexpr int ZC_SBQ = 0, ZC_SBK = 512, ZC_SBV = 1024, ZC_GMU = 1536, ZC_GMV = 2048, ZC_GDN = 2560, ZC_GDNG = 4096,
              ZC_MLQ = 4608, ZC_MLK = 4864, ZC_MLV = 5120, ZC_MLO = 5632, ZC_GATE = 6144;

#define GAS __attribute__((address_space(1)))
#define LAS __attribute__((address_space(3)))
typedef unsigned short bf16;
typedef unsigned v4u __attribute__((ext_vector_type(4)));
typedef unsigned v2u __attribute__((ext_vector_type(2)));
typedef float v4f __attribute__((ext_vector_type(4)));
typedef float v2f __attribute__((ext_vector_type(2)));
#define LDS_WAIT() asm volatile("s_waitcnt lgkmcnt(0)" ::: "memory")
#define LDS_BAR() do { asm volatile("s_waitcnt lgkmcnt(0)" ::: "memory"); __builtin_amdgcn_s_barrier(); asm volatile("" ::: "memory"); } while (0)

constexpr size_t MiB = 1u << 20;
constexpr size_t WS_CTL = 0, CTL_ZERO_BYTES = 1 * MiB;
constexpr size_t WS_WIN = 2 * MiB, WS_WBR = 58 * MiB, WS_WOUT = 66 * MiB, WS_WUP = 74 * MiB, WS_WDN = 334 * MiB;
constexpr size_t WS_XB = 464 * MiB, WS_SMALL = 496 * MiB, WS_EG = 497 * MiB, WS_BETA = WS_EG + 256 * 1024, WS_COMB = 498 * MiB;
constexpr size_t WS_Z = 500 * MiB, WS_GQ = 724 * MiB, WS_GK = 740 * MiB, WS_GV = 756 * MiB, WS_GO = 772 * MiB, WS_HO = 788 * MiB;
constexpr size_t WS_BR = 804 * MiB, WS_MTMP = 836 * MiB, WS_MSUM = 900 * MiB, WS_Y = 932 * MiB, WS_X1 = 996 * MiB, WS_X1B = 1060 * MiB;
constexpr size_t WS_XCUR = 1092 * MiB, WS_HB = 1156 * MiB, WS_YEXP = 1236 * MiB, WS_LIST = 1524 * MiB, WS_WL = 1526 * MiB, WS_SLOT = 1528 * MiB, WS_MQ = 1530 * MiB, WS_MS = 1534 * MiB, WS_MK = 1538 * MiB, WS_MV = 1542 * MiB, WS_MFL = 1552 * MiB, WS_HDEN = WS_MFL + 65536, WS_VT = 1553 * MiB, WS_END = 1561 * MiB;
constexpr size_t WS_GU = WS_GQ, WS_GNW = WS_GK, WS_GQG = WS_GK + 8 * MiB, WS_GKT = WS_GV, WS_GAT = WS_GV + 8 * MiB, WS_GDL = WS_GV + 12 * MiB;
constexpr int HROWS = 73728;
static_assert(WS_HB + (size_t)HROWS * ED * 2 <= WS_YEXP && WS_YEXP + (size_t)HROWS * D * 2 <= WS_LIST, "ws map (moe)");
static_assert(WS_WIN + (size_t)ZC * D * 2 <= WS_WBR && WS_WUP + (size_t)NEX * 1024 * D * 2 <= WS_WDN && WS_WDN + (size_t)D * HK * 2 <= WS_XB, "ws map (weights)");
static_assert(WS_Z + (size_t)T * ZC * 2 <= WS_GQ, "ws map (acts)");
constexpr int CW_BAR = 4096, CW_CNT = 16384;
constexpr int TAB_OFF = 131072 + 1024;
constexpr int LDS_BYTES = 163840, MISC_OFF = 131072 + 320;

__device__ __forceinline__ float bflo(unsigned w) { return __uint_as_float(w << 16); }
__device__ __forceinline__ float bfhi(unsigned w) { return __uint_as_float(w & 0xffff0000u); }
__device__ __forceinline__ unsigned f2bf(float f) { unsigned u = __float_as_uint(f); return (u + 0x7fffu + ((u >> 16) & 1u)) >> 16; }
typedef __bf16 bf16n2 __attribute__((ext_vector_type(2))); typedef float f32n2 __attribute__((ext_vector_type(2)));
__device__ __forceinline__ unsigned pk2(float lo, float hi) { const bf16n2 v = __builtin_convertvector((f32n2){lo, hi}, bf16n2); return __builtin_bit_cast(unsigned, v); }
__device__ __forceinline__ unsigned pk4_f8(float a, float b, float c, float d, float sc) {
    a = __builtin_amdgcn_fmed3f(a * sc, -448.f, 448.f); b = __builtin_amdgcn_fmed3f(b * sc, -448.f, 448.f); c = __builtin_amdgcn_fmed3f(c * sc, -448.f, 448.f); d = __builtin_amdgcn_fmed3f(d * sc, -448.f, 448.f);
    unsigned w = 0; w = __builtin_amdgcn_cvt_pk_fp8_f32(a, b, w, false); w = __builtin_amdgcn_cvt_pk_fp8_f32(c, d, w, true); return w; }
__device__ __forceinline__ v4f ld4(const void* base, size_t idx, bool is_bf16) {
    if (is_bf16) { const v2u r = *(const v2u*)((const unsigned short*)base + idx); return (v4f){bflo(r.x), bfhi(r.x), bflo(r.y), bfhi(r.y)}; }
    return *(const v4f*)((const float*)base + idx); }
template <int CTRL> __device__ __forceinline__ float dpp(float x) { return __builtin_bit_cast(float, __builtin_amdgcn_mov_dpp(__builtin_bit_cast(int, x), CTRL, 0xf, 0xf, true)); }
__device__ __forceinline__ float sum4(float x) { x += dpp<0xB1>(x); x += dpp<0x4E>(x); return x; }
__device__ __forceinline__ float sum8(float x) { x = sum4(x); x += dpp<0x141>(x); return x; }
__device__ __forceinline__ float sum16(float x) { x = sum8(x); x += dpp<0x140>(x); return x; }
__device__ __forceinline__ float wave_sum(float x) { x = sum16(x); x += __shfl_xor(x, 16); x += __shfl_xor(x, 32); return x; }
__device__ __forceinline__ float max8(float x) { x = fmaxf(x, dpp<0xB1>(x)); x = fmaxf(x, dpp<0x4E>(x)); x = fmaxf(x, dpp<0x141>(x)); return x; }
__device__ __forceinline__ float min8(float x) { x = fminf(x, dpp<0xB1>(x)); x = fminf(x, dpp<0x4E>(x)); x = fminf(x, dpp<0x141>(x)); return x; }
__device__ __forceinline__ float wave_scan_incl(float v) {
    v += __builtin_bit_cast(float, __builtin_amdgcn_update_dpp(0, __builtin_bit_cast(int, v), 0x111, 0xf, 0xf, true));
    v += __builtin_bit_cast(float, __builtin_amdgcn_update_dpp(0, __builtin_bit_cast(int, v), 0x112, 0xf, 0xf, true));
    v += __builtin_bit_cast(float, __builtin_amdgcn_update_dpp(0, __builtin_bit_cast(int, v), 0x114, 0xf, 0xf, true));
    v += __builtin_bit_cast(float, __builtin_amdgcn_update_dpp(0, __builtin_bit_cast(int, v), 0x118, 0xf, 0xf, true));
    v += __builtin_bit_cast(float, __builtin_amdgcn_update_dpp(0, __builtin_bit_cast(int, v), 0x142, 0xa, 0xf, false));
    v += __builtin_bit_cast(float, __builtin_amdgcn_update_dpp(0, __builtin_bit_cast(int, v), 0x143, 0xc, 0xf, false));
    return v;
}
__device__ __forceinline__ float sigmoidf_(float x) { return __builtin_amdgcn_rcpf(1.f + __expf(-x)); }
__device__ __forceinline__ float sigmoid_div(float x) { return 1.f / (1.f + __expf(-x)); }
__device__ __forceinline__ float siluf_(float x) { return x * __builtin_amdgcn_rcpf(1.f + __expf(-x)); }
__device__ __forceinline__ float softplusf_(float x) { return fmaxf(x, 0.f) + __logf(1.f + __expf(-fabsf(x))); }
__device__ __forceinline__ float gelu_tanh(float x) { const float y = 0.7978845608f * (x + 0.044715f * x * x * x); const float t = 1.f - 2.f * __builtin_amdgcn_rcpf(__expf(2.f * y) + 1.f); return 0.5f * x * (1.f + t); }
__device__ __forceinline__ void unpack8(const v4u r, float (&f)[8]) { f[0] = bflo(r.x); f[1] = bfhi(r.x); f[2] = bflo(r.y); f[3] = bfhi(r.y); f[4] = bflo(r.z); f[5] = bfhi(r.z); f[6] = bflo(r.w); f[7] = bfhi(r.w); }
#define XB_TMO      128
#define XB_XCNT(j)  (256  + 64 * (j))
#define XB_XSUB(j)  (1280 + 64 * (j))
#define XB_XGEN(j)  (2304 + 64 * (j))
#define XB_TOP      3328
#define XB_TOPGEN   3392
#define XCD_BAR_WORDS 3456
#define XB_SPIN_CAP (1u << 18)

__device__ __forceinline__ unsigned xb_ld(unsigned* p)              { return __hip_atomic_load(p, __ATOMIC_RELAXED, __HIP_MEMORY_SCOPE_AGENT); }
__device__ __forceinline__ unsigned xb_add(unsigned* p, unsigned v) { return __hip_atomic_fetch_add(p, v, __ATOMIC_RELAXED, __HIP_MEMORY_SCOPE_AGENT); }
__device__ __forceinline__ unsigned xb_xcc_id() { return (unsigned)__builtin_amdgcn_s_getreg((3 << 11) | 20) & 0xFu; }
#define XB_SPIN(cond, bar) do { unsigned _sp = 0; while (cond) { __builtin_amdgcn_s_sleep(1); \
    if ((++_sp & 255u) == 0u) { if (xb_ld(&(bar)[XB_TMO])) break; if (_sp > XB_SPIN_CAP) { atomicAdd(&(bar)[XB_TMO], 1u); break; } } } } while (0)

struct XcdBarrier {
    unsigned* bar; unsigned x;
    volatile LAS unsigned* st;
};

__device__ __forceinline__ XcdBarrier xcd_barrier_post(unsigned* bar, volatile LAS unsigned* st) {
    XcdBarrier b; b.bar = bar; b.x = xb_xcc_id(); b.st = st;
    if (threadIdx.x == 0) (void)xb_add(&bar[XB_XCNT(b.x)], 1u);
    return b;
}
__device__ __forceinline__ void xcd_barrier_complete(unsigned* bar, unsigned x, unsigned& nloc, unsigned& nx) {
    const unsigned G = gridDim.x * gridDim.y * gridDim.z;
    unsigned sum, cnt, mine, sp = 0u;
    for (;;) {
        sum = 0u; cnt = 0u; mine = 0u;
#pragma unroll
        for (unsigned j = 0; j < 16; ++j) { const unsigned c = xb_ld(&bar[XB_XCNT(j)]); sum += c; cnt += (c > 0u) ? 1u : 0u; mine = (j == x) ? c : mine; }
        if (sum == G) break;
        __builtin_amdgcn_s_sleep(1);
        if ((++sp & 255u) == 0u) { if (xb_ld(&bar[XB_TMO])) break; if (sp > XB_SPIN_CAP) { atomicAdd(&bar[XB_TMO], 1u); break; } }
    }
    nloc = mine > 0u ? mine : 1u; nx = cnt > 0u ? cnt : 1u;
}

__device__ __forceinline__ void xcd_barrier(const XcdBarrier& b) {
    asm volatile("s_waitcnt vmcnt(0)" ::: "memory");
    __syncthreads();
    if (threadIdx.x == 0) {
        unsigned* bar = b.bar;
        __builtin_amdgcn_s_waitcnt(0);
        unsigned nloc = b.st[0], nx = b.st[1];
        if (nloc == 0u) { xcd_barrier_complete(bar, b.x, nloc, nx); b.st[0] = nloc; b.st[1] = nx; }
        const unsigned old = xb_add(&bar[XB_XSUB(b.x)], 1u);
        const unsigned gen = old / nloc;
        if (old + 1u == (gen + 1u) * nloc) {
            __builtin_amdgcn_fence(__ATOMIC_RELEASE, "agent");
            asm volatile("s_waitcnt vmcnt(0)" ::: "memory");
            const unsigned og = xb_add(&bar[XB_TOP], 1u);
            const unsigned tg = og / nx;
            if (og + 1u == (tg + 1u) * nx) xb_add(&bar[XB_TOPGEN], 1u);
            else XB_SPIN(xb_ld(&bar[XB_TOPGEN]) == tg, bar);
            __builtin_amdgcn_fence(__ATOMIC_ACQUIRE, "agent");
            xb_add(&bar[XB_XGEN(b.x)], 1u);
            asm volatile("s_waitcnt vmcnt(0)" ::: "memory");
        } else {
            XB_SPIN(xb_ld(&bar[XB_XGEN(b.x)]) == gen, bar);
            __builtin_amdgcn_fence(__ATOMIC_ACQUIRE, "agent");
            asm volatile("s_waitcnt vmcnt(0)" ::: "memory");
        }
    }
    __syncthreads();
}

struct Params { const float* in[27]; float* out; unsigned char* ws; int ph_lo, ph_hi; };
enum { I_X = 0, I_WIN, I_GMNG, I_GMNB, I_GMWS, I_GMBS, I_CONVW, I_ALOG, I_DTB, I_GDNNG, I_MLIB, I_MLFB, I_MLNG, I_WBR, I_WOUT, I_LN1G, I_LN1B,
       I_WR, I_RB, I_WG, I_WU, I_WD, I_SG, I_SU, I_SD, I_LN2G, I_LN2B };

using pg8::f32x4; using pg8::u32x4; using pg8::Unit; using pg8::HALF; using pg8::BM;

struct EpiGate8 {
    static constexpr bool PERM = true, AFTER_DRAIN = false; static constexpr int MID = 0;
    unsigned char* ZG; float sc;
    __device__ __forceinline__ void operator()(const f32x4 (&acc)[2][2][4][2], const Unit& u, int wr, int wc, int fr, int fq) const {
        const int row0 = u.pm * BM + wr * 64 + fr, col0 = u.pn * BM - ZC_GATE + wc * 32 + 8 * fq; const float k = sc * GSC;
#pragma unroll
        for (int ai = 0; ai < 2; ++ai)
#pragma unroll
            for (int m = 0; m < 4; ++m)
#pragma unroll
                for (int bj = 0; bj < 2; ++bj) { const f32x4 v0 = acc[ai][bj][m][0], v1 = acc[ai][bj][m][1];
                    *(v2u*)(ZG + (size_t)(row0 + ai * HALF + m * 16) * (4 * D) + col0 + bj * HALF) = (v2u){pk4_f8(v0[0], v0[1], v0[2], v0[3], k), pk4_f8(v1[0], v1[1], v1[2], v1[3], k)}; }
    }
};
struct EpiMergeH {
    static constexpr bool PERM = true, AFTER_DRAIN = false; static constexpr int MID = MERGE_FP8 ? BW / (2 * pg8::BK) : BW / pg8::BK;
    const bf16* Z; bf16* msum;
    __device__ __forceinline__ void mid(f32x4 (&acc)[2][2][4][2], const Unit& u, int j, int wr, int wc, int fr, int fq) const {
        int row0 = u.pm * BM + wr * 64 + fr; const int col0 = u.pn * BM + wc * 32 + 8 * fq; asm volatile("" : "+v"(row0));
#if GATE_FP8
        const unsigned char* zp = (const unsigned char*)Z + (size_t)(j - 1) * D + col0;
#else
        const bf16* zp = Z + ZC_GATE + (size_t)(j - 1) * D + col0;
#endif
#if GATE_FP8
        v2u ga[2][2][2], gb[2][2][2];
#else
        v4u ga[2][2][2], gb[2][2][2];
#endif
#if GATE_FP8
#define MH_LD1(buf, m, bj, ai_, m0_) do { const unsigned char* q = zp + (size_t)(row0 + ai_ * HALF + (m0_ + m) * 16) * (4 * D) + bj * HALF; ga[buf][m][bj] = *(const v2u*)q; gb[buf][m][bj] = *(const v2u*)(q + D); } while (0)
#define MH_UNPK(w, f) do { const auto _l0 = __builtin_amdgcn_cvt_pk_f32_fp8(w.x, false), _h0 = __builtin_amdgcn_cvt_pk_f32_fp8(w.x, true), _l1 = __builtin_amdgcn_cvt_pk_f32_fp8(w.y, false), _h1 = __builtin_amdgcn_cvt_pk_f32_fp8(w.y, true); \
        f[0] = _l0[0] * (1.f / GSC); f[1] = _l0[1] * (1.f / GSC); f[2] = _h0[0] * (1.f / GSC); f[3] = _h0[1] * (1.f / GSC); f[4] = _l1[0] * (1.f / GSC); f[5] = _l1[1] * (1.f / GSC); f[6] = _h1[0] * (1.f / GSC); f[7] = _h1[1] * (1.f / GSC); } while (0)
#else
#define MH_LD1(buf, m, bj, ai_, m0_) do { const bf16* q = zp + (size_t)(row0 + ai_ * HALF + (m0_ + m) * 16) * ZC + bj * HALF; ga[buf][m][bj] = *(const v4u*)q; gb[buf][m][bj] = *(const v4u*)(q + D); } while (0)
#define MH_UNPK(w, f) unpack8(w, f)
#endif
#define MH_LOAD(buf, am_) do { const int ai_ = (am_) >> 1, m0_ = ((am_) & 1) * 2; _Pragma("unroll") for (int m = 0; m < 2; ++m) _Pragma("unroll") for (int bj = 0; bj < 2; ++bj) { \
            MH_LD1(buf, m, bj, ai_, m0_); } } while (0)
#define MH_APPLY(buf, am_) do { const int ai_ = (am_) >> 1, m0_ = ((am_) & 1) * 2; _Pragma("unroll") for (int m = 0; m < 2; ++m) _Pragma("unroll") for (int bj = 0; bj < 2; ++bj) { float a[8], b[8]; MH_UNPK(ga[buf][m][bj], a); MH_UNPK(gb[buf][m][bj], b); \
            _Pragma("unroll") for (int i = 0; i < 8; ++i) { const float ea = __builtin_amdgcn_exp2f(fmaxf(a[i], -60.f) * -1.44269504f), eb = __builtin_amdgcn_exp2f(fmaxf(b[i], -60.f) * -1.44269504f); \
                acc[ai_][bj][m0_ + m][i >> 2][i & 3] *= (1.f + eb) * __builtin_amdgcn_rcpf(1.f + ea); } } } while (0)
        MH_LOAD(0, 0); MH_LOAD(1, 1); asm volatile("" ::: "memory");
        MH_APPLY(0, 0); asm volatile("" ::: "memory"); MH_LOAD(0, 2); asm volatile("" ::: "memory");
        MH_APPLY(1, 1); asm volatile("" ::: "memory"); MH_LOAD(1, 3); asm volatile("" ::: "memory");
        MH_APPLY(0, 2); asm volatile("" ::: "memory");
        MH_APPLY(1, 3); asm volatile("" ::: "memory");
#undef MH_LOAD
#undef MH_APPLY
#undef MH_LD1
    }
    __device__ __forceinline__ void operator()(const f32x4 (&acc)[2][2][4][2], const Unit& u, int wr, int wc, int fr, int fq) const {
        const int row0 = u.pm * BM + wr * 64 + fr, col0 = u.pn * BM + wc * 32 + 8 * fq;
#pragma unroll
#if GATE_FP8
        for (int ai = 0; ai < 2; ++ai) { v2u gg[4][2];
#pragma unroll
            for (int m = 0; m < 4; ++m)
#pragma unroll
                for (int bj = 0; bj < 2; ++bj) gg[m][bj] = *(const v2u*)((const unsigned char*)Z + (size_t)(row0 + ai * HALF + m * 16) * (4 * D) + 3 * D + col0 + bj * HALF);
#else
        for (int ai = 0; ai < 2; ++ai) { v4u gg[4][2];
#pragma unroll
            for (int m = 0; m < 4; ++m)
#pragma unroll
                for (int bj = 0; bj < 2; ++bj) gg[m][bj] = *(const v4u*)(Z + (size_t)(row0 + ai * HALF + m * 16) * ZC + ZC_GATE + 3 * D + col0 + bj * HALF);
#endif
#pragma unroll
            for (int m = 0; m < 4; ++m)
#pragma unroll
                for (int bj = 0; bj < 2; ++bj) { const size_t row = (size_t)(row0 + ai * HALF + m * 16); const int col = col0 + bj * HALF; float gl[8]; MH_UNPK(gg[m][bj], gl);
                    f32x4 v0 = acc[ai][bj][m][0], v1 = acc[ai][bj][m][1];
#pragma unroll
                    for (int j = 0; j < 4; ++j) { v0[j] *= sigmoidf_(gl[j]) * MGSC; v1[j] *= sigmoidf_(gl[4 + j]) * MGSC; }
                    unsigned w0 = 0, w1 = 0; w0 = __builtin_amdgcn_cvt_pk_fp8_f32(v0[0], v0[1], w0, false); w0 = __builtin_amdgcn_cvt_pk_fp8_f32(v0[2], v0[3], w0, true); w1 = __builtin_amdgcn_cvt_pk_fp8_f32(v1[0], v1[1], w1, false); w1 = __builtin_amdgcn_cvt_pk_fp8_f32(v1[2], v1[3], w1, true);
                    *(v2u*)((unsigned char*)msum + row * D + col) = (v2u){w0, w1}; }
            asm volatile("" ::: "memory"); }
    }
};
struct EpiResid {
    static constexpr bool PERM = true, AFTER_DRAIN = false; static constexpr int MID = 0;
    const void* X; bf16* Y; float sc; bool xbf;
    __device__ __forceinline__ void operator()(const f32x4 (&acc)[2][2][4][2], const Unit& u, int wr, int wc, int fr, int fq) const {
        const int row0 = u.pm * BM + wr * 64 + fr, col0 = u.pn * BM + wc * 32 + 8 * fq;
#pragma unroll
        for (int ai = 0; ai < 2; ++ai)
#pragma unroll
            for (int m = 0; m < 4; ++m) { const size_t off = (size_t)(row0 + ai * HALF + m * 16) * D + col0;
#pragma unroll
                for (int bj = 0; bj < 2; ++bj) { const f32x4 x0 = ld4(X, off + bj * HALF, xbf), x1 = ld4(X, off + bj * HALF + 4, xbf);
                    const f32x4 v0 = x0 * ALPHA + acc[ai][bj][m][0] * sc, v1 = x1 * ALPHA + acc[ai][bj][m][1] * sc;
                    u32x4 w; w.x = pk2(v0[0], v0[1]); w.y = pk2(v0[2], v0[3]); w.z = pk2(v1[0], v1[1]); w.w = pk2(v1[2], v1[3]); *(u32x4*)(Y + off + bj * HALF) = w; } }
    }
};
struct MoeTab {
    LAS int* t; LAS unsigned short* tok; LAS float* wt; LAS unsigned char* mte;
    __device__ __forceinline__ MoeTab(LAS unsigned char* lds) : t((LAS int*)(lds + TAB_OFF)), tok((LAS unsigned short*)(lds + TAB_OFF + 1024)), wt((LAS float*)(lds + TAB_OFF + 5120)), mte((LAS unsigned char*)(lds + TAB_OFF + 13312)) {}
};
__device__ __forceinline__ void moe_tables(const MoeTab& M, const unsigned* cnt  , int tid, int lane, int wave) {
    __syncthreads();
    if (wave == 0) { const int c = (int)cnt[64 * lane]; const int tiles = (c + 255) >> 8; const float incl = wave_scan_incl((float)tiles);
        M.t[80 + lane] = c; M.t[lane] = (int)incl - tiles; if (lane == 63) { M.t[64] = (int)incl; M.t[65] = (int)incl + T / 256; M.t[80 + 64] = T; } }
    __syncthreads();
    const int Mt = M.t[65];
    for (int mt = tid; mt < Mt; mt += 512) { int e = 0;
        for (int k = 1; k <= 64; ++k) e = (M.t[k] <= mt) ? k : e;
        M.mte[mt] = (unsigned char)e; }
    __syncthreads();
}
struct UpOrder {
    MoeTab M; int n;
    __device__ __forceinline__ bool next(int i, Unit& u) const { if (i >= n) return false; u.pm = M.t[168 + i]; u.pn = M.t[176 + i]; u.aux = i; return true; }
    __device__ __forceinline__ int row_token(int i, int r) const { return (int)M.tok[i * 256 + r]; }
    __device__ __forceinline__ void a_ready(const Unit&) const {}
    __device__ __forceinline__ void done(const Unit&) const {}
};
__device__ __forceinline__ int up_order_build(const MoeTab& M, const int* LIST, const float* WL, int wg, int G, int tid) {
    const int U = 4 * M.t[65];
    if (tid < 8) { const int L = tid * G + wg; if (L < U) { const int mt = L >> 2, q = L & 3, e = M.mte[mt]; M.t[168 + tid] = mt; M.t[176 + tid] = e * 4 + q; M.t[184 + tid] = e; M.t[192 + tid] = mt - M.t[e]; } }
    int n = 0;
#pragma unroll
    for (int i = 0; i < 8; ++i) n += (i * G + wg < U) ? 1 : 0;
    __syncthreads();
    for (int idx = tid; idx < n * 256; idx += 512) { const int i = idx >> 8, r = idx & 255, e = M.t[184 + i], li = M.t[192 + i] * 256 + r;
        int tk = 0; float w = 0.f;
        if (e < NE) { if (li < M.t[80 + e]) { tk = LIST[e * T + li]; w = WL[e * T + li]; } } else { tk = li; w = 1.f; }
        M.tok[idx] = (unsigned short)tk; M.wt[idx] = w; }
    __syncthreads();
    return n;
}
struct EpiGluSparse {
    static constexpr bool PERM = true, AFTER_DRAIN = false; static constexpr int MID = 0;
    LAS const float* wt; bf16* H;
    __device__ __forceinline__ void operator()(const f32x4 (&acc)[2][2][4][2], const Unit& u, int wr, int wc, int fr, int fq) const {
        const int q = u.pn & 3; const int rl0 = wr * 64 + fr, col0 = q * 128 + wc * 32 + 8 * fq;
#pragma unroll
        for (int ai = 0; ai < 2; ++ai)
#pragma unroll
            for (int m = 0; m < 4; ++m) { const int rl = rl0 + ai * HALF + m * 16; const float c = wt[u.aux * 256 + rl]; float h[8];
#pragma unroll
                for (int n = 0; n < 2; ++n)
#pragma unroll
                    for (int j = 0; j < 4; ++j) h[4 * n + j] = siluf_(acc[ai][0][m][n][j] * UPSC) * (acc[ai][1][m][n][j] * UPSC) * c;
#if MOE_DN_FP8
#pragma unroll
                for (int j = 0; j < 8; ++j) h[j] = __builtin_amdgcn_fmed3f(h[j] * HSC, -448.f, 448.f);
                unsigned w0 = 0, w1 = 0; w0 = __builtin_amdgcn_cvt_pk_fp8_f32(h[0], h[1], w0, false); w0 = __builtin_amdgcn_cvt_pk_fp8_f32(h[2], h[3], w0, true); w1 = __builtin_amdgcn_cvt_pk_fp8_f32(h[4], h[5], w1, false); w1 = __builtin_amdgcn_cvt_pk_fp8_f32(h[6], h[7], w1, true);
                *(v2u*)((unsigned char*)H + ((size_t)u.pm * 256 + rl) * ED + col0) = (v2u){w0, w1}; }
#else
                u32x4 w; w.x = pk2(h[0], h[1]); w.y = pk2(h[2], h[3]); w.z = pk2(h[4], h[5]); w.w = pk2(h[6], h[7]);
                *(u32x4*)(H + ((size_t)u.pm * 256 + rl) * ED + col0) = w; }
#endif
    }
};
struct DownOrder {
    MoeTab M; int G, c, U;
    __device__ __forceinline__ bool next(int i, Unit& u) const { const int L = i * G + c; if (L >= U) return false; const int mt = L >> 3, e = (int)M.mte[mt]; u.pm = mt; u.pn = e * 8 + (L & 7); const int left = M.t[80 + e] - 256 * (mt - M.t[e]); u.aux = left < 256 ? left : 256; return true; }
    __device__ __forceinline__ void a_ready(const Unit&) const {}
    __device__ __forceinline__ void done(const Unit&) const {}
};
struct EpiYexp {
    static constexpr bool PERM = true, AFTER_DRAIN = false; static constexpr int MID = 0;
    bf16* Y;
    __device__ __forceinline__ void operator()(const f32x4 (&acc)[2][2][4][2], const Unit& u, int wr, int wc, int fr, int fq) const {
        const int row0 = u.pm * BM + wr * 64 + fr, col0 = (u.pn & 7) * BM + wc * 32 + 8 * fq;
#pragma unroll
        for (int ai = 0; ai < 2; ++ai)
#pragma unroll
            for (int m = 0; m < 4; ++m) { bf16* rowp = Y + (size_t)(row0 + ai * HALF + m * 16) * D + col0;
                if (wr * 64 + fr + ai * HALF + m * 16 >= u.aux) continue;
#pragma unroll
                for (int bj = 0; bj < 2; ++bj) { const f32x4 v0 = acc[ai][bj][m][0] * DNSC, v1 = acc[ai][bj][m][1] * DNSC;
#if YEXP_FP8
                    *(v2u*)((unsigned char*)Y + (size_t)(row0 + ai * HALF + m * 16) * D + col0 + bj * HALF) = (v2u){pk4_f8(v0[0], v0[1], v0[2], v0[3], YSC), pk4_f8(v1[0], v1[1], v1[2], v1[3], YSC)}; } }
#else
                    u32x4 w; w.x = pk2(v0[0], v0[1]); w.y = pk2(v0[2], v0[3]); w.z = pk2(v1[0], v1[1]); w.w = pk2(v1[2], v1[3]); *(u32x4*)(rowp + bj * HALF) = w; } }
#endif
    }
};

struct TrItem { const float* src; bf16* dst; unsigned sld, dld; int f8; };
__device__ __forceinline__ void tr_load(const TrItem& t, int lane, v4f (&v)[8]) { const int r8 = lane >> 3, c4 = lane & 7;
#pragma unroll
    for (int i = 0; i < 8; ++i) v[i] = __builtin_nontemporal_load((const v4f*)(t.src + (size_t)(8 * i + r8) * t.sld + 4 * c4)); }
__device__ __forceinline__ void tr_store(const TrItem& t, const v4f (&v)[8], LAS float* scr, int lane, bool nostore = false) {
    { const int r8 = lane >> 3, c4 = lane & 7;
#pragma unroll
      for (int i = 0; i < 8; ++i) { LAS float* d = scr + (8 * i + r8) * 33 + 4 * c4; d[0] = v[i].x; d[1] = v[i].y; d[2] = v[i].z; d[3] = v[i].w; } }
    LDS_WAIT(); asm volatile("" ::: "memory");
    if (nostore) return;
    if (t.f8) {
        const int c = lane & 3;
#pragma unroll
        for (int j = 0; j < 2; ++j) { const int n = (lane >> 2) + 16 * j; const LAS float* s = scr + (16 * c) * 33 + n; unsigned w[4];
#pragma unroll
            for (int q = 0; q < 4; ++q) { unsigned x = 0; x = __builtin_amdgcn_cvt_pk_fp8_f32(s[(4 * q) * 33] * 64.f, s[(4 * q + 1) * 33] * 64.f, x, false); x = __builtin_amdgcn_cvt_pk_fp8_f32(s[(4 * q + 2) * 33] * 64.f, s[(4 * q + 3) * 33] * 64.f, x, true); w[q] = x; }
            __builtin_nontemporal_store((v4u){w[0], w[1], w[2], w[3]}, (v4u*)((unsigned char*)t.dst + (size_t)n * t.dld + 16 * c)); }
    } else {
        const int c = lane & 7;
#pragma unroll
        for (int j = 0; j < 4; ++j) { const int n = (lane >> 3) + 8 * j; const LAS float* s = scr + (8 * c) * 33 + n;
            v4u o; o.x = pk2(s[0 * 33], s[1 * 33]); o.y = pk2(s[2 * 33], s[3 * 33]); o.z = pk2(s[4 * 33], s[5 * 33]); o.w = pk2(s[6 * 33], s[7 * 33]);
            __builtin_nontemporal_store(o, (v4u*)(t.dst + (size_t)n * t.dld + 8 * c)); }
    }
    LDS_WAIT(); asm volatile("" ::: "memory");
}
template <int PART> __device__ __forceinline__ TrItem tr_decode(const Params& p, int l, int it) {
    unsigned char* ws = p.ws;
    constexpr int N_IN = (ZC / 32) * (D / 64), N_BR = 4 * (BW / 64) * (D / 32), N_OUT = (D / 64) * (D / 32), N_UP = NEX * 2 * (D / 64) * (ED / 32);
    int r = it; TrItem t; t.f8 = 0;
    if (PART == 0) {
        const float* w_in = p.in[I_WIN] + (size_t)l * D * INC; const float* w_br = p.in[I_WBR] + (size_t)l * 4 * BW * D; const float* w_out = p.in[I_WOUT] + (size_t)l * D * D;
        bf16* WIN = (bf16*)(ws + WS_WIN); bf16* WBR = (bf16*)(ws + WS_WBR); bf16* WOUT = (bf16*)(ws + WS_WOUT);
        if (r < N_IN) { const int kb = r / (ZC / 32), n0 = (r % (ZC / 32)) * 32, k0 = kb * 64; const int sc = n0 + (n0 >= ZC_GATE ? 16 : (n0 >= ZC_MLQ ? 8 : 0));
            t.src = w_in + (size_t)k0 * INC + sc; t.sld = INC; t.dst = (bf16*)((unsigned char*)WIN + (size_t)n0 * D + k0); t.dld = D; t.f8 = 1; return t; } r -= N_IN;
        if (r < N_BR) { const int g = r / 512, rr = r % 512, k0 = (rr / 64) * 64, n0 = (rr % 64) * 32;
            t.src = w_br + ((size_t)g * BW + k0) * D + n0; t.sld = D;
#if MERGE_FP8
            t.dst = (bf16*)((unsigned char*)WBR + (size_t)n0 * BRW + g * BW + k0); t.dld = BRW; t.f8 = 1; return t; }
#else
            t.dst = WBR + (size_t)n0 * BRW + g * BW + k0; t.dld = BRW; return t; }
#endif
        r -= N_BR;
        { const int k0 = (r / 64) * 64, n0 = (r % 64) * 32; t.src = w_out + (size_t)k0 * D + n0; t.sld = D; t.dst = (bf16*)((unsigned char*)WOUT + (size_t)n0 * D + k0); t.dld = D; t.f8 = 1; return t; }
    } else {
        const float* w_g = p.in[I_WG] + (size_t)l * NE * D * ED; const float* w_u = p.in[I_WU] + (size_t)l * NE * D * ED; const float* w_d = p.in[I_WD] + (size_t)l * NE * ED * D;
        const float* s_g = p.in[I_SG] + (size_t)l * D * ED; const float* s_u = p.in[I_SU] + (size_t)l * D * ED; const float* s_d = p.in[I_SD] + (size_t)l * ED * D;
        bf16* WUP = (bf16*)(ws + WS_WUP); bf16* WDN = (bf16*)(ws + WS_WDN);
        if (r < N_UP) { const int e = r / 1024, rr = r % 1024, mat = rr / 512, r2 = rr % 512, k0 = (r2 / 16) * 64, n0 = (r2 % 16) * 32;
            const float* sb = (e < NE) ? ((mat ? w_u : w_g) + (size_t)e * D * ED) : (mat ? s_u : s_g);
            const int drow = e * 1024 + (n0 / 128) * 256 + mat * 128 + (n0 % 128);
            t.src = sb + (size_t)k0 * ED + n0; t.sld = ED;
#if MOE_UP_FP8
            t.dst = (bf16*)((unsigned char*)WUP + (size_t)drow * D + k0); t.dld = D; t.f8 = 1; return t; }
#else
            t.dst = WUP + (size_t)drow * D + k0; t.dld = D; return t; }
#endif
        r -= N_UP;
        { const int e = r / 512, rr = r % 512, k0 = (rr / 64) * 64, n0 = (rr % 64) * 32;
            const float* sb = (e < NE) ? (w_d + (size_t)e * ED * D) : s_d;
            t.src = sb + (size_t)k0 * D + n0; t.sld = D;
#if MOE_DN_FP8
            t.dst = (bf16*)((unsigned char*)WDN + ((size_t)e * D + n0) * ED + k0); t.dld = ED; t.f8 = 1; return t; }
#else
            t.dst = WDN + ((size_t)e * D + n0) * ED + k0; t.dld = ED; return t; }
#endif
    }
}
template <int PART> __device__ __forceinline__ void phase_convert(const Params& p, int l, LAS unsigned char* lds, int gw, int NGW, int wave, int lane, bool nostore = false, int lo = 0, int hi = 1 << 30) {
    constexpr int N_IN = (ZC / 32) * (D / 64), N_BR = 4 * (BW / 64) * (D / 32), N_OUT = (D / 64) * (D / 32), N_UP = NEX * 2 * (D / 64) * (ED / 32), N_DN = NEX * (ED / 64) * (D / 32);
    constexpr int NITEMS = (PART == 0) ? (N_IN + N_BR + N_OUT) : (N_UP + N_DN);
    LAS float* scr = (LAS float*)(lds + wave * 16384);
    const int NIT = hi < NITEMS ? hi : NITEMS;
    if (lo + gw >= NIT) return;
    TrItem cur = tr_decode<PART>(p, l, lo + gw); v4f va[8], vb[8];
    tr_load(cur, lane, va);
    for (int it = lo + gw; it < NIT; it += 2 * NGW) {
        const int i1 = it + NGW, i2 = it + 2 * NGW; TrItem nx = cur;
        if (i1 < NIT) { nx = tr_decode<PART>(p, l, i1); } tr_load(nx, lane, vb);
        tr_store(cur, va, scr, lane, nostore);
        if (i1 >= NIT) break;
        cur = nx; if (i2 < NIT) { cur = tr_decode<PART>(p, l, i2); } tr_load(cur, lane, va);
        tr_store(nx, vb, scr, lane, nostore);
        if (i2 >= NIT) break;
    }
}
__device__ __forceinline__ void phase_xprep(const Params& p, int l, const void* xin, bool xbf, LAS unsigned char* lds, int gw, int NGW, int tid, int lane) {
    const float* w_in = p.in[I_WIN] + (size_t)l * D * INC;
    constexpr int XP = 2052; LAS float* xt = (LAS float*)lds; LAS float* part = (LAS float*)lds;
    const int wave = tid >> 6, n_l = lane & 15, kq = lane >> 4, wg = gw >> 3, G = NGW >> 3;
    const int colw = n_l < 8 ? 4608 + n_l : 6152 + (n_l - 8);
    float bw[64];
#pragma unroll
    for (int q = 0; q < 64; ++q) bw[q] = w_in[(size_t)(256 * wave + 16 * (q >> 2) + 4 * kq + (q & 3)) * INC + colw];
    unsigned char* XB = p.ws + WS_XB; float* SMALL = (float*)(p.ws + WS_SMALL);
    __syncthreads();
    for (int tg = wg; tg < T / 16; tg += G) {
        {   v4f va[8], vb[8]; const size_t m0 = (size_t)tg * 16 + 2 * wave;
#pragma unroll
            for (int j = 0; j < 8; ++j) { va[j] = ld4(xin, m0 * D + 4 * lane + 256 * j, xbf); vb[j] = ld4(xin, (m0 + 1) * D + 4 * lane + 256 * j, xbf); }
#pragma unroll
            for (int rr = 0; rr < 2; ++rr) { unsigned* xo = (unsigned*)(XB + (m0 + rr) * D) + lane;
#pragma unroll
                for (int j = 0; j < 8; ++j) { const v4f v = rr ? vb[j] : va[j]; unsigned w = 0; w = __builtin_amdgcn_cvt_pk_fp8_f32(v.x, v.y, w, false); w = __builtin_amdgcn_cvt_pk_fp8_f32(v.z, v.w, w, true); xo[64 * j] = w;
                    *(LAS v4f*)(xt + (2 * wave + rr) * XP + 4 * lane + 256 * j) = v; } } }
        __syncthreads();
        {   pg8::f32x4 acc[4];
#pragma unroll
            for (int i = 0; i < 4; ++i) acc[i] = (pg8::f32x4){0.f, 0.f, 0.f, 0.f};
            const LAS float* xa = xt + n_l * XP + 256 * wave + 4 * kq;
#pragma unroll
            for (int s2 = 0; s2 < 16; ++s2) { const v4f a4 = *(const LAS v4f*)(xa + 16 * s2);
                acc[0] = __builtin_amdgcn_mfma_f32_16x16x4f32(a4.x, bw[4 * s2 + 0], acc[0], 0, 0, 0); acc[1] = __builtin_amdgcn_mfma_f32_16x16x4f32(a4.y, bw[4 * s2 + 1], acc[1], 0, 0, 0);
                acc[2] = __builtin_amdgcn_mfma_f32_16x16x4f32(a4.z, bw[4 * s2 + 2], acc[2], 0, 0, 0); acc[3] = __builtin_amdgcn_mfma_f32_16x16x4f32(a4.w, bw[4 * s2 + 3], acc[3], 0, 0, 0); }
            const pg8::f32x4 tot = (acc[0] + acc[1]) + (acc[2] + acc[3]);
            __syncthreads();
#pragma unroll
            for (int j = 0; j < 4; ++j) part[(wave * 16 + 4 * kq + j) * 16 + n_l] = tot[j]; }
        __syncthreads();
        if (tid < 256) { float a = 0.f;
#pragma unroll
            for (int w = 0; w < 8; ++w) a += part[w * 256 + tid];
            SMALL[(size_t)tg * 256 + tid] = a; }
        __syncthreads();
    }
}


typedef short bf16x8_t __attribute__((ext_vector_type(8)));
__device__ __forceinline__ void ml_pre_item(const Params& p, int l, LAS unsigned char* lds, int item, int tid, int wave, int lane) {
    const int h = item & 3, n = item >> 2; const size_t t0 = (size_t)n * 64;
    const bf16* Z = (const bf16*)(p.ws + WS_Z); const float* SMALL = (const float*)(p.ws + WS_SMALL);
    bf16* MQ = (bf16*)(p.ws + WS_MQ) + (size_t)item * 4096; bf16* MS = (bf16*)(p.ws + WS_MS) + (size_t)item * 4096; bf16* MK = (bf16*)(p.ws + WS_MK) + (size_t)item * 4096;
    bf16* MV = (bf16*)(p.ws + WS_MV) + (size_t)item * 9216; float* MFL = (float*)(p.ws + WS_MFL);
    LAS float* qs = (LAS float*)lds;
    LAS float* ks = qs + 64 * 65;
    LAS float* bs = ks + 64 * 65;
    LAS unsigned short* vs = (LAS unsigned short*)(bs + 128);
    { const int tk = tid >> 3, c8 = tid & 7; float f[8];
      unpack8(*(const v4u*)(Z + (t0 + tk) * ZC + ZC_MLQ + h * 64 + 8 * c8), f);
#pragma unroll
      for (int i = 0; i < 8; ++i) qs[tk * 65 + 8 * c8 + i] = f[i];
      unpack8(*(const v4u*)(Z + (t0 + tk) * ZC + ZC_MLK + h * 64 + 8 * c8), f);
#pragma unroll
      for (int i = 0; i < 8; ++i) ks[tk * 65 + 8 * c8 + i] = f[i]; }
#pragma unroll
    for (int r = 0; r < 2; ++r) { const int idx = tid + 512 * r, tk = idx >> 4, c8 = idx & 15;
        *(LAS v4u*)(vs + tk * 136 + 8 * c8) = *(const v4u*)(Z + (t0 + tk) * ZC + ZC_MLV + h * 128 + 8 * c8); }
    if (wave == 0) { const float fp = SMALL[(t0 + lane) * 16 + 12 + h] + p.in[I_MLFB][l * 4 + h]; const float lf = -softplusf_(-fp);
        bs[lane] = wave_scan_incl(lf); bs[64 + lane] = SMALL[(t0 + lane) * 16 + 8 + h] + p.in[I_MLIB][l * 4 + h]; }
    __syncthreads();
    const float blast = bs[63];
    { const int i = tid >> 3, jb = tid & 7; const float bi = bs[i];
      { const float e = __expf(bi) * 0.125f; float o[8];
#pragma unroll
        for (int x = 0; x < 8; ++x) o[x] = qs[i * 65 + 8 * jb + x] * e;
        v4u w; w.x = pk2(o[0], o[1]); w.y = pk2(o[2], o[3]); w.z = pk2(o[4], o[5]); w.w = pk2(o[6], o[7]); *(v4u*)(MQ + i * 64 + 8 * jb) = w; }
      {
          const int ti = wave >> 1, c16 = lane & 15, g4 = lane >> 4, i2 = 16 * ti + c16; const float bi2 = bs[i2];
#define ML_F8(dst, base) do { const LAS float* _b = (base); const v4u _w = (v4u){pg8::cvt_pk_bf16(_b[0], _b[1]), pg8::cvt_pk_bf16(_b[2], _b[3]), pg8::cvt_pk_bf16(_b[4], _b[5]), pg8::cvt_pk_bf16(_b[6], _b[7])}; dst = __builtin_bit_cast(bf16x8_t, _w); } while (0)
          bf16x8_t bq[2];
#pragma unroll
          for (int s2 = 0; s2 < 2; ++s2) ML_F8(bq[s2], qs + i2 * 65 + 32 * s2 + 8 * g4);
#pragma unroll
          for (int jj = 0; jj < 2; ++jj) { const int tj = 2 * (wave & 1) + jj; v2u sw = (v2u){0u, 0u};
              if (tj <= ti) { pg8::f32x4 d = {0.f, 0.f, 0.f, 0.f};
#pragma unroll
                  for (int s2 = 0; s2 < 2; ++s2) { bf16x8_t a; ML_F8(a, ks + (16 * tj + c16) * 65 + 32 * s2 + 8 * g4); d = __builtin_amdgcn_mfma_f32_16x16x32_bf16(a, bq[s2], d, 0, 0, 0); }
                  float v4[4];
#pragma unroll
                  for (int r = 0; r < 4; ++r) { const int j = 16 * tj + 4 * g4 + r; v4[r] = (j <= i2) ? __expf(bi2 - bs[j] + bs[64 + j]) * d[r] * 0.125f : 0.f; }
                  sw = (v2u){pk2(v4[0], v4[1]), pk2(v4[2], v4[3])}; }
              *(v2u*)(MS + i2 * 64 + 16 * tj + 4 * g4) = sw; }
#undef ML_F8
      }
      { float o[8];
#pragma unroll
        for (int x = 0; x < 8; ++x) { const int j = 8 * jb + x; o[x] = ks[j * 65 + i] * __expf(blast - bs[j] + bs[64 + j]); }
        v4u w; w.x = pk2(o[0], o[1]); w.y = pk2(o[2], o[3]); w.z = pk2(o[4], o[5]); w.w = pk2(o[6], o[7]); *(v4u*)(MK + i * 64 + 8 * jb) = w; }
    }
    { const int c = tid >> 2, jq = tid & 3; unsigned w[8];
#pragma unroll
      for (int x = 0; x < 8; ++x) w[x] = (unsigned)vs[(16 * jq + 2 * x) * 136 + c] | ((unsigned)vs[(16 * jq + 2 * x + 1) * 136 + c] << 16);
      *(v4u*)(MV + c * 64 + 16 * jq) = (v4u){w[0], w[1], w[2], w[3]}; *(v4u*)(MV + c * 64 + 16 * jq + 8) = (v4u){w[4], w[5], w[6], w[7]};
      if (tid < 64) { const int c2 = 128 + (tid >> 2); const unsigned one = (c2 == 128) ? 0x3F803F80u : 0u;
          *(v4u*)(MV + c2 * 64 + 16 * jq) = (v4u){one, one, one, one}; *(v4u*)(MV + c2 * 64 + 16 * jq + 8) = (v4u){one, one, one, one}; } }
    if (tid == 0) MFL[item] = __expf(blast);
    __syncthreads();
}
struct MlFrags { bf16x8_t q[2], s[2], kt[2], vt[2]; float fl; };
__device__ __forceinline__ void ml_load(MlFrags& F, const Params& p, int item, int offA, int offV) {
    const bf16* MQ = (const bf16*)(p.ws + WS_MQ) + (size_t)item * 4096; const bf16* MS = (const bf16*)(p.ws + WS_MS) + (size_t)item * 4096; const bf16* MK = (const bf16*)(p.ws + WS_MK) + (size_t)item * 4096;
    const bf16* MV = (const bf16*)(p.ws + WS_MV) + (size_t)item * 9216;
#pragma unroll
    for (int ks = 0; ks < 2; ++ks) { F.q[ks] = *(const bf16x8_t*)(MQ + offA + 32 * ks); F.s[ks] = *(const bf16x8_t*)(MS + offA + 32 * ks); F.kt[ks] = *(const bf16x8_t*)(MK + offA + 32 * ks); F.vt[ks] = *(const bf16x8_t*)(MV + offV + 32 * ks); }
    F.fl = ((const float*)(p.ws + WS_MFL))[item];
}
__device__ __forceinline__ void ml_seq(const Params& p, LAS unsigned char* lds, int wgi, int wave, int lane) {
    const int u = wgi * 2 + (wave >> 2), wi = wave & 3, h = u / 9, sl = u % 9, g = lane >> 4, c = lane & 15;
    LAS unsigned short* CT = (LAS unsigned short*)(lds + (wave >> 2) * 4096);
    float* HO = (float*)(p.ws + WS_HO); float* HDEN = (float*)(p.ws + WS_HDEN);
    const int offA = (16 * wi + c) * 64 + 8 * g, offV = (16 * sl + c) * 64 + 8 * g;
    *(LAS v2u*)(CT + c * 64 + 16 * wi + 4 * g) = (v2u){0u, 0u};
    pg8::f32x4 Cacc = {0.f, 0.f, 0.f, 0.f};
    __syncthreads();
    MlFrags F0, F1;
    ml_load(F0, p, h, offA, offV);
#define ML_STEP(F, n_) do { const int cur = (n_) & 1; \
        const bf16x8_t c0 = *(const LAS bf16x8_t*)(CT + cur * 1024 + c * 64 + 8 * g), c1 = *(const LAS bf16x8_t*)(CT + cur * 1024 + c * 64 + 32 + 8 * g); \
        pg8::f32x4 num = {0.f, 0.f, 0.f, 0.f}; \
        num = __builtin_amdgcn_mfma_f32_16x16x32_bf16(F.q[0], c0, num, 0, 0, 0); num = __builtin_amdgcn_mfma_f32_16x16x32_bf16(F.q[1], c1, num, 0, 0, 0); \
        num = __builtin_amdgcn_mfma_f32_16x16x32_bf16(F.s[0], F.vt[0], num, 0, 0, 0); num = __builtin_amdgcn_mfma_f32_16x16x32_bf16(F.s[1], F.vt[1], num, 0, 0, 0); \
        Cacc = Cacc * F.fl; \
        Cacc = __builtin_amdgcn_mfma_f32_16x16x32_bf16(F.kt[0], F.vt[0], Cacc, 0, 0, 0); Cacc = __builtin_amdgcn_mfma_f32_16x16x32_bf16(F.kt[1], F.vt[1], Cacc, 0, 0, 0); \
        { v2u w; w.x = pk2(Cacc[0], Cacc[1]); w.y = pk2(Cacc[2], Cacc[3]); *(LAS v2u*)(CT + (cur ^ 1) * 1024 + c * 64 + 16 * wi + 4 * g) = w; } \
        { const size_t tb = (size_t)(n_) * 64 + 16 * wi + 4 * g; \
          if (sl < 8) { _Pragma("unroll") for (int r = 0; r < 4; ++r) HO[(tb + r) * BW + h * 128 + 16 * sl + c] = num[r]; } \
          else if (c == 0) { _Pragma("unroll") for (int r = 0; r < 4; ++r) HDEN[(tb + r) * 4 + h] = num[r]; } } \
        LDS_BAR(); } while (0)
    for (int n = 0; n < T / 64; n += 2) {
        ml_load(F1, p, (n + 1) * 4 + h, offA, offV);
        ML_STEP(F0, n);
        ml_load(F0, p, ((n + 2 < T / 64) ? n + 2 : n) * 4 + h, offA, offV);
        ML_STEP(F1, n + 1);
    }
#undef ML_STEP
}


constexpr int QP = 132;
__device__ __forceinline__ void gdn_pre_item(const Params& p, int l, LAS unsigned char* lds, int item, int tid, int wave, int lane) {
    const int h = item & 3, n = item >> 2; const size_t t0 = (size_t)n * 64;
    const bf16* Z = (const bf16*)(p.ws + WS_Z); const float* SMALL = (const float*)(p.ws + WS_SMALL);
    float* GU = (float*)(p.ws + WS_GU) + (size_t)item * 8192; bf16* GNW = (bf16*)(p.ws + WS_GNW) + (size_t)item * 8192; bf16* GQG = (bf16*)(p.ws + WS_GQG) + (size_t)item * 8192;
    bf16* GAT = (bf16*)(p.ws + WS_GAT) + (size_t)item * 4096; bf16* GKT = (bf16*)(p.ws + WS_GKT) + (size_t)item * 8192; float* GDL = (float*)(p.ws + WS_GDL);
    const float* cw = p.in[I_CONVW] + (size_t)l * 4 * 1536;
    LAS float* qs = (LAS float*)lds; LAS float* ks = qs + 64 * QP; LAS float* vs = ks + 64 * QP; LAS float* Ls = vs + 64 * QP;   LAS float* gcs = Ls + 64 * 68; LAS float* bts = gcs + 64; LAS float* btg = bts + 64;
    LAS unsigned short* zq = (LAS unsigned short*)(lds + 131584); LAS unsigned short* zk = (LAS unsigned short*)Ls; LAS unsigned short* zv = (LAS unsigned short*)vs; LAS float* cwl = btg + 64;
    float gate_b = 0.f, gate_a = 0.f; if (wave == 0) { gate_b = SMALL[(t0 + lane) * 16 + h]; gate_a = SMALL[(t0 + lane) * 16 + 4 + h]; }
    {   v4u zr[7]; v4f wr4 = (v4f){0.f, 0.f, 0.f, 0.f};
#pragma unroll
        for (int q = 0; q < 7; ++q) { const int idx = tid + 512 * q; zr[q] = (v4u){0u, 0u, 0u, 0u};
            if (idx < 3216) { const int seg = idx / 1072, rem = idx % 1072, r = rem >> 4, c16 = rem & 15; const long tt = (long)t0 - 3 + r;
                if (tt >= 0) zr[q] = *(const v4u*)(Z + (size_t)tt * ZC + ZC_GDN + seg * 512 + h * 128 + 8 * c16); } }
        if (tid < 384) { const int j = tid / 96, rest = tid % 96, i = rest >> 5, c4 = rest & 31; wr4 = *(const v4f*)(cw + j * 1536 + i * 512 + h * 128 + 4 * c4); }
#pragma unroll
        for (int q = 0; q < 7; ++q) { const int idx = tid + 512 * q;
            if (idx < 3216) { const int seg = idx / 1072, rem = idx % 1072; LAS unsigned short* zb = seg == 0 ? zq : (seg == 1 ? zk : zv); *(LAS v4u*)(zb + 8 * rem) = zr[q]; } }
        if (tid < 384) *(LAS v4f*)(cwl + 4 * tid) = wr4;
    }
    __syncthreads();
    { const int tk = tid >> 3, part = tid & 7; float av[16];
#pragma unroll 1
      for (int i = 0; i < 3; ++i) { float a[16]; const LAS unsigned short* zb = i == 0 ? zq : (i == 1 ? zk : zv);
#pragma unroll
        for (int x = 0; x < 16; ++x) a[x] = 0.f;
#pragma unroll
        for (int j = 0; j < 4; ++j) { const LAS unsigned short* src = zb + (tk + j) * 128 + 16 * part; float x0[8], x1[8]; unpack8(*(const LAS v4u*)src, x0); unpack8(*(const LAS v4u*)(src + 8), x1);
            const LAS float* wp = cwl + (j * 3 + i) * 128 + 16 * part;
#pragma unroll
            for (int x4 = 0; x4 < 2; ++x4) { const v4f w0 = *(const LAS v4f*)(wp + 4 * x4), w1 = *(const LAS v4f*)(wp + 8 + 4 * x4);
                a[4 * x4] += w0.x * x0[4 * x4]; a[4 * x4 + 1] += w0.y * x0[4 * x4 + 1]; a[4 * x4 + 2] += w0.z * x0[4 * x4 + 2]; a[4 * x4 + 3] += w0.w * x0[4 * x4 + 3];
                a[8 + 4 * x4] += w1.x * x1[4 * x4]; a[8 + 4 * x4 + 1] += w1.y * x1[4 * x4 + 1]; a[8 + 4 * x4 + 2] += w1.z * x1[4 * x4 + 2]; a[8 + 4 * x4 + 3] += w1.w * x1[4 * x4 + 3]; } }
        float ss = 0.f;
#pragma unroll
        for (int x = 0; x < 16; ++x) { a[x] = siluf_(a[x]); ss += a[x] * a[x]; }
        if (i < 2) { ss = sum8(ss); const float r = rsqrtf(ss + 1e-6f) * (i == 0 ? 0.08838834764831845f : 1.f);
#pragma unroll
            for (int x = 0; x < 16; ++x) a[x] *= r;
            LAS float* dst = (i == 0 ? qs : ks) + tk * QP + 16 * part;
#pragma unroll
            for (int x4 = 0; x4 < 4; ++x4) *(LAS v4f*)(dst + 4 * x4) = (v4f){a[4 * x4], a[4 * x4 + 1], a[4 * x4 + 2], a[4 * x4 + 3]}; }
        else {
#pragma unroll
            for (int x = 0; x < 16; ++x) av[x] = a[x]; } }
      __syncthreads();
      { LAS float* dst = vs + tk * QP + 16 * part;
#pragma unroll
        for (int x4 = 0; x4 < 4; ++x4) *(LAS v4f*)(dst + 4 * x4) = (v4f){av[4 * x4], av[4 * x4 + 1], av[4 * x4 + 2], av[4 * x4 + 3]}; } }
    if (wave == 0) { const float bb = gate_b, aa = gate_a;
        const float g = -__expf(p.in[I_ALOG][l * 4 + h]) * softplusf_(aa + p.in[I_DTB][l * 4 + h]);
        const float gc = wave_scan_incl(g), bt = sigmoidf_(bb); gcs[lane] = gc; bts[lane] = bt; btg[lane] = bt * __expf(gc); }
    __syncthreads();
    { const int ti = wave >> 1, c16 = lane & 15, g4 = lane >> 4, i = 16 * ti + c16; const float gi = gcs[i], bi = bts[i];
#define GDN_F8(dst, base) do { const v4f _a = *(const LAS v4f*)(base), _b = *(const LAS v4f*)((base) + 4); const v4u _w = (v4u){pg8::cvt_pk_bf16(_a.x, _a.y), pg8::cvt_pk_bf16(_a.z, _a.w), pg8::cvt_pk_bf16(_b.x, _b.y), pg8::cvt_pk_bf16(_b.z, _b.w)}; dst = __builtin_bit_cast(bf16x8_t, _w); } while (0)
      bf16x8_t bk[4], bq[4];
#pragma unroll
      for (int s4 = 0; s4 < 4; ++s4) { GDN_F8(bk[s4], ks + i * QP + 32 * s4 + 8 * g4); GDN_F8(bq[s4], qs + i * QP + 32 * s4 + 8 * g4); }
#pragma unroll
      for (int jj = 0; jj < 2; ++jj) { const int tj = 2 * (wave & 1) + jj; v4f lv = (v4f){0.f, 0.f, 0.f, 0.f}; v2u aw = (v2u){0u, 0u};
          if (tj <= ti) { pg8::f32x4 dk = {0.f, 0.f, 0.f, 0.f}, dq = {0.f, 0.f, 0.f, 0.f};
#pragma unroll
              for (int s4 = 0; s4 < 4; ++s4) { bf16x8_t a; GDN_F8(a, ks + (16 * tj + c16) * QP + 32 * s4 + 8 * g4);
                  dk = __builtin_amdgcn_mfma_f32_16x16x32_bf16(a, bk[s4], dk, 0, 0, 0); dq = __builtin_amdgcn_mfma_f32_16x16x32_bf16(a, bq[s4], dq, 0, 0, 0); }
              float l4[4], a4[4];
#pragma unroll
              for (int r = 0; r < 4; ++r) { const int j = 16 * tj + 4 * g4 + r; const float dc = __expf(gi - gcs[j]); l4[r] = (j < i) ? bi * dk[r] * dc : 0.f; a4[r] = (j <= i) ? dq[r] * dc : 0.f; }
              lv = (v4f){l4[0], l4[1], l4[2], l4[3]}; aw = (v2u){pk2(a4[0], a4[1]), pk2(a4[2], a4[3])}; }
          *(LAS v4f*)(Ls + i * 68 + 16 * tj + 4 * g4) = lv; *(v2u*)(GAT + i * 64 + 16 * tj + 4 * g4) = aw; }
#undef GDN_F8
    }
    __syncthreads();
    if (tid < 256) {
        const int c = tid; int vz; asm volatile("v_mov_b32 %0, 0" : "=v"(vz));
        const LAS float* rp = (c < 128) ? (vs + c) : (ks + (c - 128)); const LAS float* mp = ((c < 128) ? bts : btg) + vz;
#define GDN_RHS(i) (rp[(i) * QP] * mp[(i)])
#define GDN_L4(i, j4) (*(const LAS v4f*)(Ls + (i) * 68 + 4 * (j4) + vz))
        float x0 = GDN_RHS(0); __builtin_amdgcn_sched_barrier(0);
        float x1 = GDN_RHS(1); { const v4f l0 = GDN_L4(1, 0); __builtin_amdgcn_sched_barrier(0); x1 -= l0.x * x0; } __builtin_amdgcn_sched_barrier(0);
        float x2 = GDN_RHS(2); { const v4f l0 = GDN_L4(2, 0); __builtin_amdgcn_sched_barrier(0); x2 -= l0.x * x0; x2 -= l0.y * x1; } __builtin_amdgcn_sched_barrier(0);
        float x3 = GDN_RHS(3); { const v4f l0 = GDN_L4(3, 0); __builtin_amdgcn_sched_barrier(0); x3 -= l0.x * x0; x3 -= l0.y * x1; x3 -= l0.z * x2; } __builtin_amdgcn_sched_barrier(0);
        float x4 = GDN_RHS(4); { const v4f l0 = GDN_L4(4, 0); __builtin_amdgcn_sched_barrier(0); x4 -= l0.x * x0; x4 -= l0.y * x1; x4 -= l0.z * x2; x4 -= l0.w * x3; } __builtin_amdgcn_sched_barrier(0);
        float x5 = GDN_RHS(5); { const v4f l0 = GDN_L4(5, 0); const v4f l1 = GDN_L4(5, 1); __builtin_amdgcn_sched_barrier(0); x5 -= l0.x * x0; x5 -= l0.y * x1; x5 -= l0.z * x2; x5 -= l0.w * x3; x5 -= l1.x * x4; } __builtin_amdgcn_sched_barrier(0);
        float x6 = GDN_RHS(6); { const v4f l0 = GDN_L4(6, 0); const v4f l1 = GDN_L4(6, 1); __builtin_amdgcn_sched_barrier(0); x6 -= l0.x * x0; x6 -= l0.y * x1; x6 -= l0.z * x2; x6 -= l0.w * x3; x6 -= l1.x * x4; x6 -= l1.y * x5; } __builtin_amdgcn_sched_barrier(0);
        float x7 = GDN_RHS(7); { const v4f l0 = GDN_L4(7, 0); const v4f l1 = GDN_L4(7, 1); __builtin_amdgcn_sched_barrier(0); x7 -= l0.x * x0; x7 -= l0.y * x1; x7 -= l0.z * x2; x7 -= l0.w * x3; x7 -= l1.x * x4; x7 -= l1.y * x5; x7 -= l1.z * x6; } __builtin_amdgcn_sched_barrier(0);
        float x8 = GDN_RHS(8); { const v4f l0 = GDN_L4(8, 0); const v4f l1 = GDN_L4(8, 1); __builtin_amdgcn_sched_barrier(0); x8 -= l0.x * x0; x8 -= l0.y * x1; x8 -= l0.z * x2; x8 -= l0.w * x3; x8 -= l1.x * x4; x8 -= l1.y * x5; x8 -= l1.z * x6; x8 -= l1.w * x7; } __builtin_amdgcn_sched_barrier(0);
        float x9 = GDN_RHS(9); { const v4f l0 = GDN_L4(9, 0); const v4f l1 = GDN_L4(9, 1); const v4f l2 = GDN_L4(9, 2); __builtin_amdgcn_sched_barrier(0); x9 -= l0.x * x0; x9 -= l0.y * x1; x9 -= l0.z * x2; x9 -= l0.w * x3; x9 -= l1.x * x4; x9 -= l1.y * x5; x9 -= l1.z * x6; x9 -= l1.w * x7; x9 -= l2.x * x8; } __builtin_amdgcn_sched_barrier(0);
        float x10 = GDN_RHS(10); { const v4f l0 = GDN_L4(10, 0); const v4f l1 = GDN_L4(10, 1); const v4f l2 = GDN_L4(10, 2); __builtin_amdgcn_sched_barrier(0); x10 -= l0.x * x0; x10 -= l0.y * x1; x10 -= l0.z * x2; x10 -= l0.w * x3; x10 -= l1.x * x4; x10 -= l1.y * x5; x10 -= l1.z * x6; x10 -= l1.w * x7; x10 -= l2.x * x8; x10 -= l2.y * x9; } __builtin_amdgcn_sched_barrier(0);
        float x11 = GDN_RHS(11); { const v4f l0 = GDN_L4(11, 0); const v4f l1 = GDN_L4(11, 1); const v4f l2 = GDN_L4(11, 2); __builtin_amdgcn_sched_barrier(0); x11 -= l0.x * x0; x11 -= l0.y * x1; x11 -= l0.z * x2; x11 -= l0.w * x3; x11 -= l1.x * x4; x11 -= l1.y * x5; x11 -= l1.z * x6; x11 -= l1.w * x7; x11 -= l2.x * x8; x11 -= l2.y * x9; x11 -= l2.z * x10; } __builtin_amdgcn_sched_barrier(0);
        float x12 = GDN_RHS(12); { const v4f l0 = GDN_L4(12, 0); const v4f l1 = GDN_L4(12, 1); const v4f l2 = GDN_L4(12, 2); __builtin_amdgcn_sched_barrier(0); x12 -= l0.x * x0; x12 -= l0.y * x1; x12 -= l0.z * x2; x12 -= l0.w * x3; x12 -= l1.x * x4; x12 -= l1.y * x5; x12 -= l1.z * x6; x12 -= l1.w * x7; x12 -= l2.x * x8; x12 -= l2.y * x9; x12 -= l2.z * x10; x12 -= l2.w * x11; } __builtin_amdgcn_sched_barrier(0);
        float x13 = GDN_RHS(13); { const v4f l0 = GDN_L4(13, 0); const v4f l1 = GDN_L4(13, 1); const v4f l2 = GDN_L4(13, 2); const v4f l3 = GDN_L4(13, 3); __builtin_amdgcn_sched_barrier(0); x13 -= l0.x * x0; x13 -= l0.y * x1; x13 -= l0.z * x2; x13 -= l0.w * x3; x13 -= l1.x * x4; x13 -= l1.y * x5; x13 -= l1.z * x6; x13 -= l1.w * x7; x13 -= l2.x * x8; x13 -= l2.y * x9; x13 -= l2.z * x10; x13 -= l2.w * x11; x13 -= l3.x * x12; } __builtin_amdgcn_sched_barrier(0);
        float x14 = GDN_RHS(14); { const v4f l0 = GDN_L4(14, 0); const v4f l1 = GDN_L4(14, 1); const v4f l2 = GDN_L4(14, 2); const v4f l3 = GDN_L4(14, 3); __builtin_amdgcn_sched_barrier(0); x14 -= l0.x * x0; x14 -= l0.y * x1; x14 -= l0.z * x2; x14 -= l0.w * x3; x14 -= l1.x * x4; x14 -= l1.y * x5; x14 -= l1.z * x6; x14 -= l1.w * x7; x14 -= l2.x * x8; x14 -= l2.y * x9; x14 -= l2.z * x10; x14 -= l2.w * x11; x14 -= l3.x * x12; x14 -= l3.y * x13; } __builtin_amdgcn_sched_barrier(0);
        float x15 = GDN_RHS(15); { const v4f l0 = GDN_L4(15, 0); const v4f l1 = GDN_L4(15, 1); const v4f l2 = GDN_L4(15, 2); const v4f l3 = GDN_L4(15, 3); __builtin_amdgcn_sched_barrier(0); x15 -= l0.x * x0; x15 -= l0.y * x1; x15 -= l0.z * x2; x15 -= l0.w * x3; x15 -= l1.x * x4; x15 -= l1.y * x5; x15 -= l1.z * x6; x15 -= l1.w * x7; x15 -= l2.x * x8; x15 -= l2.y * x9; x15 -= l2.z * x10; x15 -= l2.w * x11; x15 -= l3.x * x12; x15 -= l3.y * x13; x15 -= l3.z * x14; } __builtin_amdgcn_sched_barrier(0);
        float x16 = GDN_RHS(16); { const v4f l0 = GDN_L4(16, 0); const v4f l1 = GDN_L4(16, 1); const v4f l2 = GDN_L4(16, 2); const v4f l3 = GDN_L4(16, 3); __builtin_amdgcn_sched_barrier(0); x16 -= l0.x * x0; x16 -= l0.y * x1; x16 -= l0.z * x2; x16 -= l0.w * x3; x16 -= l1.x * x4; x16 -= l1.y * x5; x16 -= l1.z * x6; x16 -= l1.w * x7; x16 -= l2.x * x8; x16 -= l2.y * x9; x16 -= l2.z * x10; x16 -= l2.w * x11; x16 -= l3.x * x12; x16 -= l3.y * x13; x16 -= l3.z * x14; x16 -= l3.w * x15; } __builtin_amdgcn_sched_barrier(0);
        float x17 = GDN_RHS(17); { const v4f l0 = GDN_L4(17, 0); const v4f l1 = GDN_L4(17, 1); const v4f l2 = GDN_L4(17, 2); const v4f l3 = GDN_L4(17, 3); const v4f l4 = GDN_L4(17, 4); __builtin_amdgcn_sched_barrier(0); x17 -= l0.x * x0; x17 -= l0.y * x1; x17 -= l0.z * x2; x17 -= l0.w * x3; x17 -= l1.x * x4; x17 -= l1.y * x5; x17 -= l1.z * x6; x17 -= l1.w * x7; x17 -= l2.x * x8; x17 -= l2.y * x9; x17 -= l2.z * x10; x17 -= l2.w * x11; x17 -= l3.x * x12; x17 -= l3.y * x13; x17 -= l3.z * x14; x17 -= l3.w * x15; x17 -= l4.x * x16; } __builtin_amdgcn_sched_barrier(0);
        float x18 = GDN_RHS(18); { const v4f l0 = GDN_L4(18, 0); const v4f l1 = GDN_L4(18, 1); const v4f l2 = GDN_L4(18, 2); const v4f l3 = GDN_L4(18, 3); const v4f l4 = GDN_L4(18, 4); __builtin_amdgcn_sched_barrier(0); x18 -= l0.x * x0; x18 -= l0.y * x1; x18 -= l0.z * x2; x18 -= l0.w * x3; x18 -= l1.x * x4; x18 -= l1.y * x5; x18 -= l1.z * x6; x18 -= l1.w * x7; x18 -= l2.x * x8; x18 -= l2.y * x9; x18 -= l2.z * x10; x18 -= l2.w * x11; x18 -= l3.x * x12; x18 -= l3.y * x13; x18 -= l3.z * x14; x18 -= l3.w * x15; x18 -= l4.x * x16; x18 -= l4.y * x17; } __builtin_amdgcn_sched_barrier(0);
        float x19 = GDN_RHS(19); { const v4f l0 = GDN_L4(19, 0); const v4f l1 = GDN_L4(19, 1); const v4f l2 = GDN_L4(19, 2); const v4f l3 = GDN_L4(19, 3); const v4f l4 = GDN_L4(19, 4); __builtin_amdgcn_sched_barrier(0); x19 -= l0.x * x0; x19 -= l0.y * x1; x19 -= l0.z * x2; x19 -= l0.w * x3; x19 -= l1.x * x4; x19 -= l1.y * x5; x19 -= l1.z * x6; x19 -= l1.w * x7; x19 -= l2.x * x8; x19 -= l2.y * x9; x19 -= l2.z * x10; x19 -= l2.w * x11; x19 -= l3.x * x12; x19 -= l3.y * x13; x19 -= l3.z * x14; x19 -= l3.w * x15; x19 -= l4.x * x16; x19 -= l4.y * x17; x19 -= l4.z * x18; } __builtin_amdgcn_sched_barrier(0);
        float x20 = GDN_RHS(20); { const v4f l0 = GDN_L4(20, 0); const v4f l1 = GDN_L4(20, 1); const v4f l2 = GDN_L4(20, 2); const v4f l3 = GDN_L4(20, 3); const v4f l4 = GDN_L4(20, 4); __builtin_amdgcn_sched_barrier(0); x20 -= l0.x * x0; x20 -= l0.y * x1; x20 -= l0.z * x2; x20 -= l0.w * x3; x20 -= l1.x * x4; x20 -= l1.y * x5; x20 -= l1.z * x6; x20 -= l1.w * x7; x20 -= l2.x * x8; x20 -= l2.y * x9; x20 -= l2.z * x10; x20 -= l2.w * x11; x20 -= l3.x * x12; x20 -= l3.y * x13; x20 -= l3.z * x14; x20 -= l3.w * x15; x20 -= l4.x * x16; x20 -= l4.y * x17; x20 -= l4.z * x18; x20 -= l4.w * x19; } __builtin_amdgcn_sched_barrier(0);
        float x21 = GDN_RHS(21); { const v4f l0 = GDN_L4(21, 0); const v4f l1 = GDN_L4(21, 1); const v4f l2 = GDN_L4(21, 2); const v4f l3 = GDN_L4(21, 3); const v4f l4 = GDN_L4(21, 4); const v4f l5 = GDN_L4(21, 5); __builtin_amdgcn_sched_barrier(0); x21 -= l0.x * x0; x21 -= l0.y * x1; x21 -= l0.z * x2; x21 -= l0.w * x3; x21 -= l1.x * x4; x21 -= l1.y * x5; x21 -= l1.z * x6; x21 -= l1.w * x7; x21 -= l2.x * x8; x21 -= l2.y * x9; x21 -= l2.z * x10; x21 -= l2.w * x11; x21 -= l3.x * x12; x21 -= l3.y * x13; x21 -= l3.z * x14; x21 -= l3.w * x15; x21 -= l4.x * x16; x21 -= l4.y * x17; x21 -= l4.z * x18; x21 -= l4.w * x19; x21 -= l5.x * x20; } __builtin_amdgcn_sched_barrier(0);
        float x22 = GDN_RHS(22); { const v4f l0 = GDN_L4(22, 0); const v4f l1 = GDN_L4(22, 1); const v4f l2 = GDN_L4(22, 2); const v4f l3 = GDN_L4(22, 3); const v4f l4 = GDN_L4(22, 4); const v4f l5 = GDN_L4(22, 5); __builtin_amdgcn_sched_barrier(0); x22 -= l0.x * x0; x22 -= l0.y * x1; x22 -= l0.z * x2; x22 -= l0.w * x3; x22 -= l1.x * x4; x22 -= l1.y * x5; x22 -= l1.z * x6; x22 -= l1.w * x7; x22 -= l2.x * x8; x22 -= l2.y * x9; x22 -= l2.z * x10; x22 -= l2.w * x11; x22 -= l3.x * x12; x22 -= l3.y * x13; x22 -= l3.z * x14; x22 -= l3.w * x15; x22 -= l4.x * x16; x22 -= l4.y * x17; x22 -= l4.z * x18; x22 -= l4.w * x19; x22 -= l5.x * x20; x22 -= l5.y * x21; } __builtin_amdgcn_sched_barrier(0);
        float x23 = GDN_RHS(23); { const v4f l0 = GDN_L4(23, 0); const v4f l1 = GDN_L4(23, 1); const v4f l2 = GDN_L4(23, 2); const v4f l3 = GDN_L4(23, 3); const v4f l4 = GDN_L4(23, 4); const v4f l5 = GDN_L4(23, 5); __builtin_amdgcn_sched_barrier(0); x23 -= l0.x * x0; x23 -= l0.y * x1; x23 -= l0.z * x2; x23 -= l0.w * x3; x23 -= l1.x * x4; x23 -= l1.y * x5; x23 -= l1.z * x6; x23 -= l1.w * x7; x23 -= l2.x * x8; x23 -= l2.y * x9; x23 -= l2.z * x10; x23 -= l2.w * x11; x23 -= l3.x * x12; x23 -= l3.y * x13; x23 -= l3.z * x14; x23 -= l3.w * x15; x23 -= l4.x * x16; x23 -= l4.y * x17; x23 -= l4.z * x18; x23 -= l4.w * x19; x23 -= l5.x * x20; x23 -= l5.y * x21; x23 -= l5.z * x22; } __builtin_amdgcn_sched_barrier(0);
        float x24 = GDN_RHS(24); { const v4f l0 = GDN_L4(24, 0); const v4f l1 = GDN_L4(24, 1); const v4f l2 = GDN_L4(24, 2); const v4f l3 = GDN_L4(24, 3); const v4f l4 = GDN_L4(24, 4); const v4f l5 = GDN_L4(24, 5); __builtin_amdgcn_sched_barrier(0); x24 -= l0.x * x0; x24 -= l0.y * x1; x24 -= l0.z * x2; x24 -= l0.w * x3; x24 -= l1.x * x4; x24 -= l1.y * x5; x24 -= l1.z * x6; x24 -= l1.w * x7; x24 -= l2.x * x8; x24 -= l2.y * x9; x24 -= l2.z * x10; x24 -= l2.w * x11; x24 -= l3.x * x12; x24 -= l3.y * x13; x24 -= l3.z * x14; x24 -= l3.w * x15; x24 -= l4.x * x16; x24 -= l4.y * x17; x24 -= l4.z * x18; x24 -= l4.w * x19; x24 -= l5.x * x20; x24 -= l5.y * x21; x24 -= l5.z * x22; x24 -= l5.w * x23; } __builtin_amdgcn_sched_barrier(0);
        float x25 = GDN_RHS(25); { const v4f l0 = GDN_L4(25, 0); const v4f l1 = GDN_L4(25, 1); const v4f l2 = GDN_L4(25, 2); const v4f l3 = GDN_L4(25, 3); const v4f l4 = GDN_L4(25, 4); const v4f l5 = GDN_L4(25, 5); __builtin_amdgcn_sched_barrier(0); x25 -= l0.x * x0; x25 -= l0.y * x1; x25 -= l0.z * x2; x25 -= l0.w * x3; x25 -= l1.x * x4; x25 -= l1.y * x5; x25 -= l1.z * x6; x25 -= l1.w * x7; x25 -= l2.x * x8; x25 -= l2.y * x9; x25 -= l2.z * x10; x25 -= l2.w * x11; x25 -= l3.x * x12; x25 -= l3.y * x13; x25 -= l3.z * x14; x25 -= l3.w * x15; x25 -= l4.x * x16; x25 -= l4.y * x17; x25 -= l4.z * x18; x25 -= l4.w * x19; x25 -= l5.x * x20; x25 -= l5.y * x21; x25 -= l5.z * x22; x25 -= l5.w * x23; } __builtin_amdgcn_sched_barrier(0); { const v4f l6 = GDN_L4(25, 6); __builtin_amdgcn_sched_barrier(0); x25 -= l6.x * x24; } __builtin_amdgcn_sched_barrier(0);
        float x26 = GDN_RHS(26); { const v4f l0 = GDN_L4(26, 0); const v4f l1 = GDN_L4(26, 1); const v4f l2 = GDN_L4(26, 2); const v4f l3 = GDN_L4(26, 3); const v4f l4 = GDN_L4(26, 4); const v4f l5 = GDN_L4(26, 5); __builtin_amdgcn_sched_barrier(0); x26 -= l0.x * x0; x26 -= l0.y * x1; x26 -= l0.z * x2; x26 -= l0.w * x3; x26 -= l1.x * x4; x26 -= l1.y * x5; x26 -= l1.z * x6; x26 -= l1.w * x7; x26 -= l2.x * x8; x26 -= l2.y * x9; x26 -= l2.z * x10; x26 -= l2.w * x11; x26 -= l3.x * x12; x26 -= l3.y * x13; x26 -= l3.z * x14; x26 -= l3.w * x15; x26 -= l4.x * x16; x26 -= l4.y * x17; x26 -= l4.z * x18; x26 -= l4.w * x19; x26 -= l5.x * x20; x26 -= l5.y * x21; x26 -= l5.z * x22; x26 -= l5.w * x23; } __builtin_amdgcn_sched_barrier(0); { const v4f l6 = GDN_L4(26, 6); __builtin_amdgcn_sched_barrier(0); x26 -= l6.x * x24; x26 -= l6.y * x25; } __builtin_amdgcn_sched_barrier(0);
        float x27 = GDN_RHS(27); { const v4f l0 = GDN_L4(27, 0); const v4f l1 = GDN_L4(27, 1); const v4f l2 = GDN_L4(27, 2); const v4f l3 = GDN_L4(27, 3); const v4f l4 = GDN_L4(27, 4); const v4f l5 = GDN_L4(27, 5); __builtin_amdgcn_sched_barrier(0); x27 -= l0.x * x0; x27 -= l0.y * x1; x27 -= l0.z * x2; x27 -= l0.w * x3; x27 -= l1.x * x4; x27 -= l1.y * x5; x27 -= l1.z * x6; x27 -= l1.w * x7; x27 -= l2.x * x8; x27 -= l2.y * x9; x27 -= l2.z * x10; x27 -= l2.w * x11; x27 -= l3.x * x12; x27 -= l3.y * x13; x27 -= l3.z * x14; x27 -= l3.w * x15; x27 -= l4.x * x16; x27 -= l4.y * x17; x27 -= l4.z * x18; x27 -= l4.w * x19; x27 -= l5.x * x20; x27 -= l5.y * x21; x27 -= l5.z * x22; x27 -= l5.w * x23; } __builtin_amdgcn_sched_barrier(0); { const v4f l6 = GDN_L4(27, 6); __builtin_amdgcn_sched_barrier(0); x27 -= l6.x * x24; x27 -= l6.y * x25; x27 -= l6.z * x26; } __builtin_amdgcn_sched_barrier(0);
        float x28 = GDN_RHS(28); { const v4f l0 = GDN_L4(28, 0); const v4f l1 = GDN_L4(28, 1); const v4f l2 = GDN_L4(28, 2); const v4f l3 = GDN_L4(28, 3); const v4f l4 = GDN_L4(28, 4); const v4f l5 = GDN_L4(28, 5); __builtin_amdgcn_sched_barrier(0); x28 -= l0.x * x0; x28 -= l0.y * x1; x28 -= l0.z * x2; x28 -= l0.w * x3; x28 -= l1.x * x4; x28 -= l1.y * x5; x28 -= l1.z * x6; x28 -= l1.w * x7; x28 -= l2.x * x8; x28 -= l2.y * x9; x28 -= l2.z * x10; x28 -= l2.w * x11; x28 -= l3.x * x12; x28 -= l3.y * x13; x28 -= l3.z * x14; x28 -= l3.w * x15; x28 -= l4.x * x16; x28 -= l4.y * x17; x28 -= l4.z * x18; x28 -= l4.w * x19; x28 -= l5.x * x20; x28 -= l5.y * x21; x28 -= l5.z * x22; x28 -= l5.w * x23; } __builtin_amdgcn_sched_barrier(0); { const v4f l6 = GDN_L4(28, 6); __builtin_amdgcn_sched_barrier(0); x28 -= l6.x * x24; x28 -= l6.y * x25; x28 -= l6.z * x26; x28 -= l6.w * x27; } __builtin_amdgcn_sched_barrier(0);
        float x29 = GDN_RHS(29); { const v4f l0 = GDN_L4(29, 0); const v4f l1 = GDN_L4(29, 1); const v4f l2 = GDN_L4(29, 2); const v4f l3 = GDN_L4(29, 3); const v4f l4 = GDN_L4(29, 4); const v4f l5 = GDN_L4(29, 5); __builtin_amdgcn_sched_barrier(0); x29 -= l0.x * x0; x29 -= l0.y * x1; x29 -= l0.z * x2; x29 -= l0.w * x3; x29 -= l1.x * x4; x29 -= l1.y * x5; x29 -= l1.z * x6; x29 -= l1.w * x7; x29 -= l2.x * x8; x29 -= l2.y * x9; x29 -= l2.z * x10; x29 -= l2.w * x11; x29 -= l3.x * x12; x29 -= l3.y * x13; x29 -= l3.z * x14; x29 -= l3.w * x15; x29 -= l4.x * x16; x29 -= l4.y * x17; x29 -= l4.z * x18; x29 -= l4.w * x19; x29 -= l5.x * x20; x29 -= l5.y * x21; x29 -= l5.z * x22; x29 -= l5.w * x23; } __builtin_amdgcn_sched_barrier(0); { const v4f l6 = GDN_L4(29, 6); const v4f l7 = GDN_L4(29, 7); __builtin_amdgcn_sched_barrier(0); x29 -= l6.x * x24; x29 -= l6.y * x25; x29 -= l6.z * x26; x29 -= l6.w * x27; x29 -= l7.x * x28; } __builtin_amdgcn_sched_barrier(0);
        float x30 = GDN_RHS(30); { const v4f l0 = GDN_L4(30, 0); const v4f l1 = GDN_L4(30, 1); const v4f l2 = GDN_L4(30, 2); const v4f l3 = GDN_L4(30, 3); const v4f l4 = GDN_L4(30, 4); const v4f l5 = GDN_L4(30, 5); __builtin_amdgcn_sched_barrier(0); x30 -= l0.x * x0; x30 -= l0.y * x1; x30 -= l0.z * x2; x30 -= l0.w * x3; x30 -= l1.x * x4; x30 -= l1.y * x5; x30 -= l1.z * x6; x30 -= l1.w * x7; x30 -= l2.x * x8; x30 -= l2.y * x9; x30 -= l2.z * x10; x30 -= l2.w * x11; x30 -= l3.x * x12; x30 -= l3.y * x13; x30 -= l3.z * x14; x30 -= l3.w * x15; x30 -= l4.x * x16; x30 -= l4.y * x17; x30 -= l4.z * x18; x30 -= l4.w * x19; x30 -= l5.x * x20; x30 -= l5.y * x21; x30 -= l5.z * x22; x30 -= l5.w * x23; } __builtin_amdgcn_sched_barrier(0); { const v4f l6 = GDN_L4(30, 6); const v4f l7 = GDN_L4(30, 7); __builtin_amdgcn_sched_barrier(0); x30 -= l6.x * x24; x30 -= l6.y * x25; x30 -= l6.z * x26; x30 -= l6.w * x27; x30 -= l7.x * x28; x30 -= l7.y * x29; } __builtin_amdgcn_sched_barrier(0);
        float x31 = GDN_RHS(31); { const v4f l0 = GDN_L4(31, 0); const v4f l1 = GDN_L4(31, 1); const v4f l2 = GDN_L4(31, 2); const v4f l3 = GDN_L4(31, 3); const v4f l4 = GDN_L4(31, 4); const v4f l5 = GDN_L4(31, 5); __builtin_amdgcn_sched_barrier(0); x31 -= l0.x * x0; x31 -= l0.y * x1; x31 -= l0.z * x2; x31 -= l0.w * x3; x31 -= l1.x * x4; x31 -= l1.y * x5; x31 -= l1.z * x6; x31 -= l1.w * x7; x31 -= l2.x * x8; x31 -= l2.y * x9; x31 -= l2.z * x10; x31 -= l2.w * x11; x31 -= l3.x * x12; x31 -= l3.y * x13; x31 -= l3.z * x14; x31 -= l3.w * x15; x31 -= l4.x * x16; x31 -= l4.y * x17; x31 -= l4.z * x18; x31 -= l4.w * x19; x31 -= l5.x * x20; x31 -= l5.y * x21; x31 -= l5.z * x22; x31 -= l5.w * x23; } __builtin_amdgcn_sched_barrier(0); { const v4f l6 = GDN_L4(31, 6); const v4f l7 = GDN_L4(31, 7); __builtin_amdgcn_sched_barrier(0); x31 -= l6.x * x24; x31 -= l6.y * x25; x31 -= l6.z * x26; x31 -= l6.w * x27; x31 -= l7.x * x28; x31 -= l7.y * x29; x31 -= l7.z * x30; } __builtin_amdgcn_sched_barrier(0);
        float x32 = GDN_RHS(32); { const v4f l0 = GDN_L4(32, 0); const v4f l1 = GDN_L4(32, 1); const v4f l2 = GDN_L4(32, 2); const v4f l3 = GDN_L4(32, 3); const v4f l4 = GDN_L4(32, 4); const v4f l5 = GDN_L4(32, 5); __builtin_amdgcn_sched_barrier(0); x32 -= l0.x * x0; x32 -= l0.y * x1; x32 -= l0.z * x2; x32 -= l0.w * x3; x32 -= l1.x * x4; x32 -= l1.y * x5; x32 -= l1.z * x6; x32 -= l1.w * x7; x32 -= l2.x * x8; x32 -= l2.y * x9; x32 -= l2.z * x10; x32 -= l2.w * x11; x32 -= l3.x * x12; x32 -= l3.y * x13; x32 -= l3.z * x14; x32 -= l3.w * x15; x32 -= l4.x * x16; x32 -= l4.y * x17; x32 -= l4.z * x18; x32 -= l4.w * x19; x32 -= l5.x * x20; x32 -= l5.y * x21; x32 -= l5.z * x22; x32 -= l5.w * x23; } __builtin_amdgcn_sched_barrier(0); { const v4f l6 = GDN_L4(32, 6); const v4f l7 = GDN_L4(32, 7); __builtin_amdgcn_sched_barrier(0); x32 -= l6.x * x24; x32 -= l6.y * x25; x32 -= l6.z * x26; x32 -= l6.w * x27; x32 -= l7.x * x28; x32 -= l7.y * x29; x32 -= l7.z * x30; x32 -= l7.w * x31; } __builtin_amdgcn_sched_barrier(0);
        float x33 = GDN_RHS(33); { const v4f l0 = GDN_L4(33, 0); const v4f l1 = GDN_L4(33, 1); const v4f l2 = GDN_L4(33, 2); const v4f l3 = GDN_L4(33, 3); const v4f l4 = GDN_L4(33, 4); const v4f l5 = GDN_L4(33, 5); __builtin_amdgcn_sched_barrier(0); x33 -= l0.x * x0; x33 -= l0.y * x1; x33 -= l0.z * x2; x33 -= l0.w * x3; x33 -= l1.x * x4; x33 -= l1.y * x5; x33 -= l1.z * x6; x33 -= l1.w * x7; x33 -= l2.x * x8; x33 -= l2.y * x9; x33 -= l2.z * x10; x33 -= l2.w * x11; x33 -= l3.x * x12; x33 -= l3.y * x13; x33 -= l3.z * x14; x33 -= l3.w * x15; x33 -= l4.x * x16; x33 -= l4.y * x17; x33 -= l4.z * x18; x33 -= l4.w * x19; x33 -= l5.x * x20; x33 -= l5.y * x21; x33 -= l5.z * x22; x33 -= l5.w * x23; } __builtin_amdgcn_sched_barrier(0); { const v4f l6 = GDN_L4(33, 6); const v4f l7 = GDN_L4(33, 7); const v4f l8 = GDN_L4(33, 8); __builtin_amdgcn_sched_barrier(0); x33 -= l6.x * x24; x33 -= l6.y * x25; x33 -= l6.z * x26; x33 -= l6.w * x27; x33 -= l7.x * x28; x33 -= l7.y * x29; x33 -= l7.z * x30; x33 -= l7.w * x31; x33 -= l8.x * x32; } __builtin_amdgcn_sched_barrier(0);
        float x34 = GDN_RHS(34); { const v4f l0 = GDN_L4(34, 0); const v4f l1 = GDN_L4(34, 1); const v4f l2 = GDN_L4(34, 2); const v4f l3 = GDN_L4(34, 3); const v4f l4 = GDN_L4(34, 4); const v4f l5 = GDN_L4(34, 5); __builtin_amdgcn_sched_barrier(0); x34 -= l0.x * x0; x34 -= l0.y * x1; x34 -= l0.z * x2; x34 -= l0.w * x3; x34 -= l1.x * x4; x34 -= l1.y * x5; x34 -= l1.z * x6; x34 -= l1.w * x7; x34 -= l2.x * x8; x34 -= l2.y * x9; x34 -= l2.z * x10; x34 -= l2.w * x11; x34 -= l3.x * x12; x34 -= l3.y * x13; x34 -= l3.z * x14; x34 -= l3.w * x15; x34 -= l4.x * x16; x34 -= l4.y * x17; x34 -= l4.z * x18; x34 -= l4.w * x19; x34 -= l5.x * x20; x34 -= l5.y * x21; x34 -= l5.z * x22; x34 -= l5.w * x23; } __builtin_amdgcn_sched_barrier(0); { const v4f l6 = GDN_L4(34, 6); const v4f l7 = GDN_L4(34, 7); const v4f l8 = GDN_L4(34, 8); __builtin_amdgcn_sched_barrier(0); x34 -= l6.x * x24; x34 -= l6.y * x25; x34 -= l6.z * x26; x34 -= l6.w * x27; x34 -= l7.x * x28; x34 -= l7.y * x29; x34 -= l7.z * x30; x34 -= l7.w * x31; x34 -= l8.x * x32; x34 -= l8.y * x33; } __builtin_amdgcn_sched_barrier(0);
        float x35 = GDN_RHS(35); { const v4f l0 = GDN_L4(35, 0); const v4f l1 = GDN_L4(35, 1); const v4f l2 = GDN_L4(35, 2); const v4f l3 = GDN_L4(35, 3); const v4f l4 = GDN_L4(35, 4); const v4f l5 = GDN_L4(35, 5); __builtin_amdgcn_sched_barrier(0); x35 -= l0.x * x0; x35 -= l0.y * x1; x35 -= l0.z * x2; x35 -= l0.w * x3; x35 -= l1.x * x4; x35 -= l1.y * x5; x35 -= l1.z * x6; x35 -= l1.w * x7; x35 -= l2.x * x8; x35 -= l2.y * x9; x35 -= l2.z * x10; x35 -= l2.w * x11; x35 -= l3.x * x12; x35 -= l3.y * x13; x35 -= l3.z * x14; x35 -= l3.w * x15; x35 -= l4.x * x16; x35 -= l4.y * x17; x35 -= l4.z * x18; x35 -= l4.w * x19; x35 -= l5.x * x20; x35 -= l5.y * x21; x35 -= l5.z * x22; x35 -= l5.w * x23; } __builtin_amdgcn_sched_barrier(0); { const v4f l6 = GDN_L4(35, 6); const v4f l7 = GDN_L4(35, 7); const v4f l8 = GDN_L4(35, 8); __builtin_amdgcn_sched_barrier(0); x35 -= l6.x * x24; x35 -= l6.y * x25; x35 -= l6.z * x26; x35 -= l6.w * x27; x35 -= l7.x * x28; x35 -= l7.y * x29; x35 -= l7.z * x30; x35 -= l7.w * x31; x35 -= l8.x * x32; x35 -= l8.y * x33; x35 -= l8.z * x34; } __builtin_amdgcn_sched_barrier(0);
        float x36 = GDN_RHS(36); { const v4f l0 = GDN_L4(36, 0); const v4f l1 = GDN_L4(36, 1); const v4f l2 = GDN_L4(36, 2); const v4f l3 = GDN_L4(36, 3); const v4f l4 = GDN_L4(36, 4); const v4f l5 = GDN_L4(36, 5); __builtin_amdgcn_sched_barrier(0); x36 -= l0.x * x0; x36 -= l0.y * x1; x36 -= l0.z * x2; x36 -= l0.w * x3; x36 -= l1.x * x4; x36 -= l1.y * x5; x36 -= l1.z * x6; x36 -= l1.w * x7; x36 -= l2.x * x8; x36 -= l2.y * x9; x36 -= l2.z * x10; x36 -= l2.w * x11; x36 -= l3.x * x12; x36 -= l3.y * x13; x36 -= l3.z * x14; x36 -= l3.w * x15; x36 -= l4.x * x16; x36 -= l4.y * x17; x36 -= l4.z * x18; x36 -= l4.w * x19; x36 -= l5.x * x20; x36 -= l5.y * x21; x36 -= l5.z * x22; x36 -= l5.w * x23; } __builtin_amdgcn_sched_barrier(0); { const v4f l6 = GDN_L4(36, 6); const v4f l7 = GDN_L4(36, 7); const v4f l8 = GDN_L4(36, 8); __builtin_amdgcn_sched_barrier(0); x36 -= l6.x * x24; x36 -= l6.y * x25; x36 -= l6.z * x26; x36 -= l6.w * x27; x36 -= l7.x * x28; x36 -= l7.y * x29; x36 -= l7.z * x30; x36 -= l7.w * x31; x36 -= l8.x * x32; x36 -= l8.y * x33; x36 -= l8.z * x34; x36 -= l8.w * x35; } __builtin_amdgcn_sched_barrier(0);
        float x37 = GDN_RHS(37); { const v4f l0 = GDN_L4(37, 0); const v4f l1 = GDN_L4(37, 1); const v4f l2 = GDN_L4(37, 2); const v4f l3 = GDN_L4(37, 3); const v4f l4 = GDN_L4(37, 4); const v4f l5 = GDN_L4(37, 5); __builtin_amdgcn_sched_barrier(0); x37 -= l0.x * x0; x37 -= l0.y * x1; x37 -= l0.z * x2; x37 -= l0.w * x3; x37 -= l1.x * x4; x37 -= l1.y * x5; x37 -= l1.z * x6; x37 -= l1.w * x7; x37 -= l2.x * x8; x37 -= l2.y * x9; x37 -= l2.z * x10; x37 -= l2.w * x11; x37 -= l3.x * x12; x37 -= l3.y * x13; x37 -= l3.z * x14; x37 -= l3.w * x15; x37 -= l4.x * x16; x37 -= l4.y * x17; x37 -= l4.z * x18; x37 -= l4.w * x19; x37 -= l5.x * x20; x37 -= l5.y * x21; x37 -= l5.z * x22; x37 -= l5.w * x23; } __builtin_amdgcn_sched_barrier(0); { const v4f l6 = GDN_L4(37, 6); const v4f l7 = GDN_L4(37, 7); const v4f l8 = GDN_L4(37, 8); const v4f l9 = GDN_L4(37, 9); __builtin_amdgcn_sched_barrier(0); x37 -= l6.x * x24; x37 -= l6.y * x25; x37 -= l6.z * x26; x37 -= l6.w * x27; x37 -= l7.x * x28; x37 -= l7.y * x29; x37 -= l7.z * x30; x37 -= l7.w * x31; x37 -= l8.x * x32; x37 -= l8.y * x33; x37 -= l8.z * x34; x37 -= l8.w * x35; x37 -= l9.x * x36; } __builtin_amdgcn_sched_barrier(0);
        float x38 = GDN_RHS(38); { const v4f l0 = GDN_L4(38, 0); const v4f l1 = GDN_L4(38, 1); const v4f l2 = GDN_L4(38, 2); const v4f l3 = GDN_L4(38, 3); const v4f l4 = GDN_L4(38, 4); const v4f l5 = GDN_L4(38, 5); __builtin_amdgcn_sched_barrier(0); x38 -= l0.x * x0; x38 -= l0.y * x1; x38 -= l0.z * x2; x38 -= l0.w * x3; x38 -= l1.x * x4; x38 -= l1.y * x5; x38 -= l1.z * x6; x38 -= l1.w * x7; x38 -= l2.x * x8; x38 -= l2.y * x9; x38 -= l2.z * x10; x38 -= l2.w * x11; x38 -= l3.x * x12; x38 -= l3.y * x13; x38 -= l3.z * x14; x38 -= l3.w * x15; x38 -= l4.x * x16; x38 -= l4.y * x17; x38 -= l4.z * x18; x38 -= l4.w * x19; x38 -= l5.x * x20; x38 -= l5.y * x21; x38 -= l5.z * x22; x38 -= l5.w * x23; } __builtin_amdgcn_sched_barrier(0); { const v4f l6 = GDN_L4(38, 6); const v4f l7 = GDN_L4(38, 7); const v4f l8 = GDN_L4(38, 8); const v4f l9 = GDN_L4(38, 9); __builtin_amdgcn_sched_barrier(0); x38 -= l6.x * x24; x38 -= l6.y * x25; x38 -= l6.z * x26; x38 -= l6.w * x27; x38 -= l7.x * x28; x38 -= l7.y * x29; x38 -= l7.z * x30; x38 -= l7.w * x31; x38 -= l8.x * x32; x38 -= l8.y * x33; x38 -= l8.z * x34; x38 -= l8.w * x35; x38 -= l9.x * x36; x38 -= l9.y * x37; } __builtin_amdgcn_sched_barrier(0);
        float x39 = GDN_RHS(39); { const v4f l0 = GDN_L4(39, 0); const v4f l1 = GDN_L4(39, 1); const v4f l2 = GDN_L4(39, 2); const v4f l3 = GDN_L4(39, 3); const v4f l4 = GDN_L4(39, 4); const v4f l5 = GDN_L4(39, 5); __builtin_amdgcn_sched_barrier(0); x39 -= l0.x * x0; x39 -= l0.y * x1; x39 -= l0.z * x2; x39 -= l0.w * x3; x39 -= l1.x * x4; x39 -= l1.y * x5; x39 -= l1.z * x6; x39 -= l1.w * x7; x39 -= l2.x * x8; x39 -= l2.y * x9; x39 -= l2.z * x10; x39 -= l2.w * x11; x39 -= l3.x * x12; x39 -= l3.y * x13; x39 -= l3.z * x14; x39 -= l3.w * x15; x39 -= l4.x * x16; x39 -= l4.y * x17; x39 -= l4.z * x18; x39 -= l4.w * x19; x39 -= l5.x * x20; x39 -= l5.y * x21; x39 -= l5.z * x22; x39 -= l5.w * x23; } __builtin_amdgcn_sched_barrier(0); { const v4f l6 = GDN_L4(39, 6); const v4f l7 = GDN_L4(39, 7); const v4f l8 = GDN_L4(39, 8); const v4f l9 = GDN_L4(39, 9); __builtin_amdgcn_sched_barrier(0); x39 -= l6.x * x24; x39 -= l6.y * x25; x39 -= l6.z * x26; x39 -= l6.w * x27; x39 -= l7.x * x28; x39 -= l7.y * x29; x39 -= l7.z * x30; x39 -= l7.w * x31; x39 -= l8.x * x32; x39 -= l8.y * x33; x39 -= l8.z * x34; x39 -= l8.w * x35; x39 -= l9.x * x36; x39 -= l9.y * x37; x39 -= l9.z * x38; } __builtin_amdgcn_sched_barrier(0);
        float x40 = GDN_RHS(40); { const v4f l0 = GDN_L4(40, 0); const v4f l1 = GDN_L4(40, 1); const v4f l2 = GDN_L4(40, 2); const v4f l3 = GDN_L4(40, 3); const v4f l4 = GDN_L4(40, 4); const v4f l5 = GDN_L4(40, 5); __builtin_amdgcn_sched_barrier(0); x40 -= l0.x * x0; x40 -= l0.y * x1; x40 -= l0.z * x2; x40 -= l0.w * x3; x40 -= l1.x * x4; x40 -= l1.y * x5; x40 -= l1.z * x6; x40 -= l1.w * x7; x40 -= l2.x * x8; x40 -= l2.y * x9; x40 -= l2.z * x10; x40 -= l2.w * x11; x40 -= l3.x * x12; x40 -= l3.y * x13; x40 -= l3.z * x14; x40 -= l3.w * x15; x40 -= l4.x * x16; x40 -= l4.y * x17; x40 -= l4.z * x18; x40 -= l4.w * x19; x40 -= l5.x * x20; x40 -= l5.y * x21; x40 -= l5.z * x22; x40 -= l5.w * x23; } __builtin_amdgcn_sched_barrier(0); { const v4f l6 = GDN_L4(40, 6); const v4f l7 = GDN_L4(40, 7); const v4f l8 = GDN_L4(40, 8); const v4f l9 = GDN_L4(40, 9); __builtin_amdgcn_sched_barrier(0); x40 -= l6.x * x24; x40 -= l6.y * x25; x40 -= l6.z * x26; x40 -= l6.w * x27; x40 -= l7.x * x28; x40 -= l7.y * x29; x40 -= l7.z * x30; x40 -= l7.w * x31; x40 -= l8.x * x32; x40 -= l8.y * x33; x40 -= l8.z * x34; x40 -= l8.w * x35; x40 -= l9.x * x36; x40 -= l9.y * x37; x40 -= l9.z * x38; x40 -= l9.w * x39; } __builtin_amdgcn_sched_barrier(0);
        float x41 = GDN_RHS(41); { const v4f l0 = GDN_L4(41, 0); const v4f l1 = GDN_L4(41, 1); const v4f l2 = GDN_L4(41, 2); const v4f l3 = GDN_L4(41, 3); const v4f l4 = GDN_L4(41, 4); const v4f l5 = GDN_L4(41, 5); __builtin_amdgcn_sched_barrier(0); x41 -= l0.x * x0; x41 -= l0.y * x1; x41 -= l0.z * x2; x41 -= l0.w * x3; x41 -= l1.x * x4; x41 -= l1.y * x5; x41 -= l1.z * x6; x41 -= l1.w * x7; x41 -= l2.x * x8; x41 -= l2.y * x9; x41 -= l2.z * x10; x41 -= l2.w * x11; x41 -= l3.x * x12; x41 -= l3.y * x13; x41 -= l3.z * x14; x41 -= l3.w * x15; x41 -= l4.x * x16; x41 -= l4.y * x17; x41 -= l4.z * x18; x41 -= l4.w * x19; x41 -= l5.x * x20; x41 -= l5.y * x21; x41 -= l5.z * x22; x41 -= l5.w * x23; } __builtin_amdgcn_sched_barrier(0); { const v4f l6 = GDN_L4(41, 6); const v4f l7 = GDN_L4(41, 7); const v4f l8 = GDN_L4(41, 8); const v4f l9 = GDN_L4(41, 9); const v4f l10 = GDN_L4(41, 10); __builtin_amdgcn_sched_barrier(0); x41 -= l6.x * x24; x41 -= l6.y * x25; x41 -= l6.z * x26; x41 -= l6.w * x27; x41 -= l7.x * x28; x41 -= l7.y * x29; x41 -= l7.z * x30; x41 -= l7.w * x31; x41 -= l8.x * x32; x41 -= l8.y * x33; x41 -= l8.z * x34; x41 -= l8.w * x35; x41 -= l9.x * x36; x41 -= l9.y * x37; x41 -= l9.z * x38; x41 -= l9.w * x39; x41 -= l10.x * x40; } __builtin_amdgcn_sched_barrier(0);
        float x42 = GDN_RHS(42); { const v4f l0 = GDN_L4(42, 0); const v4f l1 = GDN_L4(42, 1); const v4f l2 = GDN_L4(42, 2); const v4f l3 = GDN_L4(42, 3); const v4f l4 = GDN_L4(42, 4); const v4f l5 = GDN_L4(42, 5); __builtin_amdgcn_sched_barrier(0); x42 -= l0.x * x0; x42 -= l0.y * x1; x42 -= l0.z * x2; x42 -= l0.w * x3; x42 -= l1.x * x4; x42 -= l1.y * x5; x42 -= l1.z * x6; x42 -= l1.w * x7; x42 -= l2.x * x8; x42 -= l2.y * x9; x42 -= l2.z * x10; x42 -= l2.w * x11; x42 -= l3.x * x12; x42 -= l3.y * x13; x42 -= l3.z * x14; x42 -= l3.w * x15; x42 -= l4.x * x16; x42 -= l4.y * x17; x42 -= l4.z * x18; x42 -= l4.w * x19; x42 -= l5.x * x20; x42 -= l5.y * x21; x42 -= l5.z * x22; x42 -= l5.w * x23; } __builtin_amdgcn_sched_barrier(0); { const v4f l6 = GDN_L4(42, 6); const v4f l7 = GDN_L4(42, 7); const v4f l8 = GDN_L4(42, 8); const v4f l9 = GDN_L4(42, 9); const v4f l10 = GDN_L4(42, 10); __builtin_amdgcn_sched_barrier(0); x42 -= l6.x * x24; x42 -= l6.y * x25; x42 -= l6.z * x26; x42 -= l6.w * x27; x42 -= l7.x * x28; x42 -= l7.y * x29; x42 -= l7.z * x30; x42 -= l7.w * x31; x42 -= l8.x * x32; x42 -= l8.y * x33; x42 -= l8.z * x34; x42 -= l8.w * x35; x42 -= l9.x * x36; x42 -= l9.y * x37; x42 -= l9.z * x38; x42 -= l9.w * x39; x42 -= l10.x * x40; x42 -= l10.y * x41; } __builtin_amdgcn_sched_barrier(0);
        float x43 = GDN_RHS(43); { const v4f l0 = GDN_L4(43, 0); const v4f l1 = GDN_L4(43, 1); const v4f l2 = GDN_L4(43, 2); const v4f l3 = GDN_L4(43, 3); const v4f l4 = GDN_L4(43, 4); const v4f l5 = GDN_L4(43, 5); __builtin_amdgcn_sched_barrier(0); x43 -= l0.x * x0; x43 -= l0.y * x1; x43 -= l0.z * x2; x43 -= l0.w * x3; x43 -= l1.x * x4; x43 -= l1.y * x5; x43 -= l1.z * x6; x43 -= l1.w * x7; x43 -= l2.x * x8; x43 -= l2.y * x9; x43 -= l2.z * x10; x43 -= l2.w * x11; x43 -= l3.x * x12; x43 -= l3.y * x13; x43 -= l3.z * x14; x43 -= l3.w * x15; x43 -= l4.x * x16; x43 -= l4.y * x17; x43 -= l4.z * x18; x43 -= l4.w * x19; x43 -= l5.x * x20; x43 -= l5.y * x21; x43 -= l5.z * x22; x43 -= l5.w * x23; } __builtin_amdgcn_sched_barrier(0); { const v4f l6 = GDN_L4(43, 6); const v4f l7 = GDN_L4(43, 7); const v4f l8 = GDN_L4(43, 8); const v4f l9 = GDN_L4(43, 9); const v4f l10 = GDN_L4(43, 10); __builtin_amdgcn_sched_barrier(0); x43 -= l6.x * x24; x43 -= l6.y * x25; x43 -= l6.z * x26; x43 -= l6.w * x27; x43 -= l7.x * x28; x43 -= l7.y * x29; x43 -= l7.z * x30; x43 -= l7.w * x31; x43 -= l8.x * x32; x43 -= l8.y * x33; x43 -= l8.z * x34; x43 -= l8.w * x35; x43 -= l9.x * x36; x43 -= l9.y * x37; x43 -= l9.z * x38; x43 -= l9.w * x39; x43 -= l10.x * x40; x43 -= l10.y * x41; x43 -= l10.z * x42; } __builtin_amdgcn_sched_barrier(0);
        float x44 = GDN_RHS(44); { const v4f l0 = GDN_L4(44, 0); const v4f l1 = GDN_L4(44, 1); const v4f l2 = GDN_L4(44, 2); const v4f l3 = GDN_L4(44, 3); const v4f l4 = GDN_L4(44, 4); const v4f l5 = GDN_L4(44, 5); __builtin_amdgcn_sched_barrier(0); x44 -= l0.x * x0; x44 -= l0.y * x1; x44 -= l0.z * x2; x44 -= l0.w * x3; x44 -= l1.x * x4; x44 -= l1.y * x5; x44 -= l1.z * x6; x44 -= l1.w * x7; x44 -= l2.x * x8; x44 -= l2.y * x9; x44 -= l2.z * x10; x44 -= l2.w * x11; x44 -= l3.x * x12; x44 -= l3.y * x13; x44 -= l3.z * x14; x44 -= l3.w * x15; x44 -= l4.x * x16; x44 -= l4.y * x17; x44 -= l4.z * x18; x44 -= l4.w * x19; x44 -= l5.x * x20; x44 -= l5.y * x21; x44 -= l5.z * x22; x44 -= l5.w * x23; } __builtin_amdgcn_sched_barrier(0); { const v4f l6 = GDN_L4(44, 6); const v4f l7 = GDN_L4(44, 7); const v4f l8 = GDN_L4(44, 8); const v4f l9 = GDN_L4(44, 9); const v4f l10 = GDN_L4(44, 10); __builtin_amdgcn_sched_barrier(0); x44 -= l6.x * x24; x44 -= l6.y * x25; x44 -= l6.z * x26; x44 -= l6.w * x27; x44 -= l7.x * x28; x44 -= l7.y * x29; x44 -= l7.z * x30; x44 -= l7.w * x31; x44 -= l8.x * x32; x44 -= l8.y * x33; x44 -= l8.z * x34; x44 -= l8.w * x35; x44 -= l9.x * x36; x44 -= l9.y * x37; x44 -= l9.z * x38; x44 -= l9.w * x39; x44 -= l10.x * x40; x44 -= l10.y * x41; x44 -= l10.z * x42; x44 -= l10.w * x43; } __builtin_amdgcn_sched_barrier(0);
        float x45 = GDN_RHS(45); { const v4f l0 = GDN_L4(45, 0); const v4f l1 = GDN_L4(45, 1); const v4f l2 = GDN_L4(45, 2); const v4f l3 = GDN_L4(45, 3); const v4f l4 = GDN_L4(45, 4); const v4f l5 = GDN_L4(45, 5); __builtin_amdgcn_sched_barrier(0); x45 -= l0.x * x0; x45 -= l0.y * x1; x45 -= l0.z * x2; x45 -= l0.w * x3; x45 -= l1.x * x4; x45 -= l1.y * x5; x45 -= l1.z * x6; x45 -= l1.w * x7; x45 -= l2.x * x8; x45 -= l2.y * x9; x45 -= l2.z * x10; x45 -= l2.w * x11; x45 -= l3.x * x12; x45 -= l3.y * x13; x45 -= l3.z * x14; x45 -= l3.w * x15; x45 -= l4.x * x16; x45 -= l4.y * x17; x45 -= l4.z * x18; x45 -= l4.w * x19; x45 -= l5.x * x20; x45 -= l5.y * x21; x45 -= l5.z * x22; x45 -= l5.w * x23; } __builtin_amdgcn_sched_barrier(0); { const v4f l6 = GDN_L4(45, 6); const v4f l7 = GDN_L4(45, 7); const v4f l8 = GDN_L4(45, 8); const v4f l9 = GDN_L4(45, 9); const v4f l10 = GDN_L4(45, 10); const v4f l11 = GDN_L4(45, 11); __builtin_amdgcn_sched_barrier(0); x45 -= l6.x * x24; x45 -= l6.y * x25; x45 -= l6.z * x26; x45 -= l6.w * x27; x45 -= l7.x * x28; x45 -= l7.y * x29; x45 -= l7.z * x30; x45 -= l7.w * x31; x45 -= l8.x * x32; x45 -= l8.y * x33; x45 -= l8.z * x34; x45 -= l8.w * x35; x45 -= l9.x * x36; x45 -= l9.y * x37; x45 -= l9.z * x38; x45 -= l9.w * x39; x45 -= l10.x * x40; x45 -= l10.y * x41; x45 -= l10.z * x42; x45 -= l10.w * x43; x45 -= l11.x * x44; } __builtin_amdgcn_sched_barrier(0);
        float x46 = GDN_RHS(46); { const v4f l0 = GDN_L4(46, 0); const v4f l1 = GDN_L4(46, 1); const v4f l2 = GDN_L4(46, 2); const v4f l3 = GDN_L4(46, 3); const v4f l4 = GDN_L4(46, 4); const v4f l5 = GDN_L4(46, 5); __builtin_amdgcn_sched_barrier(0); x46 -= l0.x * x0; x46 -= l0.y * x1; x46 -= l0.z * x2; x46 -= l0.w * x3; x46 -= l1.x * x4; x46 -= l1.y * x5; x46 -= l1.z * x6; x46 -= l1.w * x7; x46 -= l2.x * x8; x46 -= l2.y * x9; x46 -= l2.z * x10; x46 -= l2.w * x11; x46 -= l3.x * x12; x46 -= l3.y * x13; x46 -= l3.z * x14; x46 -= l3.w * x15; x46 -= l4.x * x16; x46 -= l4.y * x17; x46 -= l4.z * x18; x46 -= l4.w * x19; x46 -= l5.x * x20; x46 -= l5.y * x21; x46 -= l5.z * x22; x46 -= l5.w * x23; } __builtin_amdgcn_sched_barrier(0); { const v4f l6 = GDN_L4(46, 6); const v4f l7 = GDN_L4(46, 7); const v4f l8 = GDN_L4(46, 8); const v4f l9 = GDN_L4(46, 9); const v4f l10 = GDN_L4(46, 10); const v4f l11 = GDN_L4(46, 11); __builtin_amdgcn_sched_barrier(0); x46 -= l6.x * x24; x46 -= l6.y * x25; x46 -= l6.z * x26; x46 -= l6.w * x27; x46 -= l7.x * x28; x46 -= l7.y * x29; x46 -= l7.z * x30; x46 -= l7.w * x31; x46 -= l8.x * x32; x46 -= l8.y * x33; x46 -= l8.z * x34; x46 -= l8.w * x35; x46 -= l9.x * x36; x46 -= l9.y * x37; x46 -= l9.z * x38; x46 -= l9.w * x39; x46 -= l10.x * x40; x46 -= l10.y * x41; x46 -= l10.z * x42; x46 -= l10.w * x43; x46 -= l11.x * x44; x46 -= l11.y * x45; } __builtin_amdgcn_sched_barrier(0);
        float x47 = GDN_RHS(47); { const v4f l0 = GDN_L4(47, 0); const v4f l1 = GDN_L4(47, 1); const v4f l2 = GDN_L4(47, 2); const v4f l3 = GDN_L4(47, 3); const v4f l4 = GDN_L4(47, 4); const v4f l5 = GDN_L4(47, 5); __builtin_amdgcn_sched_barrier(0); x47 -= l0.x * x0; x47 -= l0.y * x1; x47 -= l0.z * x2; x47 -= l0.w * x3; x47 -= l1.x * x4; x47 -= l1.y * x5; x47 -= l1.z * x6; x47 -= l1.w * x7; x47 -= l2.x * x8; x47 -= l2.y * x9; x47 -= l2.z * x10; x47 -= l2.w * x11; x47 -= l3.x * x12; x47 -= l3.y * x13; x47 -= l3.z * x14; x47 -= l3.w * x15; x47 -= l4.x * x16; x47 -= l4.y * x17; x47 -= l4.z * x18; x47 -= l4.w * x19; x47 -= l5.x * x20; x47 -= l5.y * x21; x47 -= l5.z * x22; x47 -= l5.w * x23; } __builtin_amdgcn_sched_barrier(0); { const v4f l6 = GDN_L4(47, 6); const v4f l7 = GDN_L4(47, 7); const v4f l8 = GDN_L4(47, 8); const v4f l9 = GDN_L4(47, 9); const v4f l10 = GDN_L4(47, 10); const v4f l11 = GDN_L4(47, 11); __builtin_amdgcn_sched_barrier(0); x47 -= l6.x * x24; x47 -= l6.y * x25; x47 -= l6.z * x26; x47 -= l6.w * x27; x47 -= l7.x * x28; x47 -= l7.y * x29; x47 -= l7.z * x30; x47 -= l7.w * x31; x47 -= l8.x * x32; x47 -= l8.y * x33; x47 -= l8.z * x34; x47 -= l8.w * x35; x47 -= l9.x * x36; x47 -= l9.y * x37; x47 -= l9.z * x38; x47 -= l9.w * x39; x47 -= l10.x * x40; x47 -= l10.y * x41; x47 -= l10.z * x42; x47 -= l10.w * x43; x47 -= l11.x * x44; x47 -= l11.y * x45; x47 -= l11.z * x46; } __builtin_amdgcn_sched_barrier(0);
        float x48 = GDN_RHS(48); { const v4f l0 = GDN_L4(48, 0); const v4f l1 = GDN_L4(48, 1); const v4f l2 = GDN_L4(48, 2); const v4f l3 = GDN_L4(48, 3); const v4f l4 = GDN_L4(48, 4); const v4f l5 = GDN_L4(48, 5); __builtin_amdgcn_sched_barrier(0); x48 -= l0.x * x0; x48 -= l0.y * x1; x48 -= l0.z * x2; x48 -= l0.w * x3; x48 -= l1.x * x4; x48 -= l1.y * x5; x48 -= l1.z * x6; x48 -= l1.w * x7; x48 -= l2.x * x8; x48 -= l2.y * x9; x48 -= l2.z * x10; x48 -= l2.w * x11; x48 -= l3.x * x12; x48 -= l3.y * x13; x48 -= l3.z * x14; x48 -= l3.w * x15; x48 -= l4.x * x16; x48 -= l4.y * x17; x48 -= l4.z * x18; x48 -= l4.w * x19; x48 -= l5.x * x20; x48 -= l5.y * x21; x48 -= l5.z * x22; x48 -= l5.w * x23; } __builtin_amdgcn_sched_barrier(0); { const v4f l6 = GDN_L4(48, 6); const v4f l7 = GDN_L4(48, 7); const v4f l8 = GDN_L4(48, 8); const v4f l9 = GDN_L4(48, 9); const v4f l10 = GDN_L4(48, 10); const v4f l11 = GDN_L4(48, 11); __builtin_amdgcn_sched_barrier(0); x48 -= l6.x * x24; x48 -= l6.y * x25; x48 -= l6.z * x26; x48 -= l6.w * x27; x48 -= l7.x * x28; x48 -= l7.y * x29; x48 -= l7.z * x30; x48 -= l7.w * x31; x48 -= l8.x * x32; x48 -= l8.y * x33; x48 -= l8.z * x34; x48 -= l8.w * x35; x48 -= l9.x * x36; x48 -= l9.y * x37; x48 -= l9.z * x38; x48 -= l9.w * x39; x48 -= l10.x * x40; x48 -= l10.y * x41; x48 -= l10.z * x42; x48 -= l10.w * x43; x48 -= l11.x * x44; x48 -= l11.y * x45; x48 -= l11.z * x46; x48 -= l11.w * x47; } __builtin_amdgcn_sched_barrier(0);
        float x49 = GDN_RHS(49); { const v4f l0 = GDN_L4(49, 0); const v4f l1 = GDN_L4(49, 1); const v4f l2 = GDN_L4(49, 2); const v4f l3 = GDN_L4(49, 3); const v4f l4 = GDN_L4(49, 4); const v4f l5 = GDN_L4(49, 5); __builtin_amdgcn_sched_barrier(0); x49 -= l0.x * x0; x49 -= l0.y * x1; x49 -= l0.z * x2; x49 -= l0.w * x3; x49 -= l1.x * x4; x49 -= l1.y * x5; x49 -= l1.z * x6; x49 -= l1.w * x7; x49 -= l2.x * x8; x49 -= l2.y * x9; x49 -= l2.z * x10; x49 -= l2.w * x11; x49 -= l3.x * x12; x49 -= l3.y * x13; x49 -= l3.z * x14; x49 -= l3.w * x15; x49 -= l4.x * x16; x49 -= l4.y * x17; x49 -= l4.z * x18; x49 -= l4.w * x19; x49 -= l5.x * x20; x49 -= l5.y * x21; x49 -= l5.z * x22; x49 -= l5.w * x23; } __builtin_amdgcn_sched_barrier(0); { const v4f l6 = GDN_L4(49, 6); const v4f l7 = GDN_L4(49, 7); const v4f l8 = GDN_L4(49, 8); const v4f l9 = GDN_L4(49, 9); const v4f l10 = GDN_L4(49, 10); const v4f l11 = GDN_L4(49, 11); __builtin_amdgcn_sched_barrier(0); x49 -= l6.x * x24; x49 -= l6.y * x25; x49 -= l6.z * x26; x49 -= l6.w * x27; x49 -= l7.x * x28; x49 -= l7.y * x29; x49 -= l7.z * x30; x49 -= l7.w * x31; x49 -= l8.x * x32; x49 -= l8.y * x33; x49 -= l8.z * x34; x49 -= l8.w * x35; x49 -= l9.x * x36; x49 -= l9.y * x37; x49 -= l9.z * x38; x49 -= l9.w * x39; x49 -= l10.x * x40; x49 -= l10.y * x41; x49 -= l10.z * x42; x49 -= l10.w * x43; x49 -= l11.x * x44; x49 -= l11.y * x45; x49 -= l11.z * x46; x49 -= l11.w * x47; } __builtin_amdgcn_sched_barrier(0); { const v4f l12 = GDN_L4(49, 12); __builtin_amdgcn_sched_barrier(0); x49 -= l12.x * x48; } __builtin_amdgcn_sched_barrier(0);
        float x50 = GDN_RHS(50); { const v4f l0 = GDN_L4(50, 0); const v4f l1 = GDN_L4(50, 1); const v4f l2 = GDN_L4(50, 2); const v4f l3 = GDN_L4(50, 3); const v4f l4 = GDN_L4(50, 4); const v4f l5 = GDN_L4(50, 5); __builtin_amdgcn_sched_barrier(0); x50 -= l0.x * x0; x50 -= l0.y * x1; x50 -= l0.z * x2; x50 -= l0.w * x3; x50 -= l1.x * x4; x50 -= l1.y * x5; x50 -= l1.z * x6; x50 -= l1.w * x7; x50 -= l2.x * x8; x50 -= l2.y * x9; x50 -= l2.z * x10; x50 -= l2.w * x11; x50 -= l3.x * x12; x50 -= l3.y * x13; x50 -= l3.z * x14; x50 -= l3.w * x15; x50 -= l4.x * x16; x50 -= l4.y * x17; x50 -= l4.z * x18; x50 -= l4.w * x19; x50 -= l5.x * x20; x50 -= l5.y * x21; x50 -= l5.z * x22; x50 -= l5.w * x23; } __builtin_amdgcn_sched_barrier(0); { const v4f l6 = GDN_L4(50, 6); const v4f l7 = GDN_L4(50, 7); const v4f l8 = GDN_L4(50, 8); const v4f l9 = GDN_L4(50, 9); const v4f l10 = GDN_L4(50, 10); const v4f l11 = GDN_L4(50, 11); __builtin_amdgcn_sched_barrier(0); x50 -= l6.x * x24; x50 -= l6.y * x25; x50 -= l6.z * x26; x50 -= l6.w * x27; x50 -= l7.x * x28; x50 -= l7.y * x29; x50 -= l7.z * x30; x50 -= l7.w * x31; x50 -= l8.x * x32; x50 -= l8.y * x33; x50 -= l8.z * x34; x50 -= l8.w * x35; x50 -= l9.x * x36; x50 -= l9.y * x37; x50 -= l9.z * x38; x50 -= l9.w * x39; x50 -= l10.x * x40; x50 -= l10.y * x41; x50 -= l10.z * x42; x50 -= l10.w * x43; x50 -= l11.x * x44; x50 -= l11.y * x45; x50 -= l11.z * x46; x50 -= l11.w * x47; } __builtin_amdgcn_sched_barrier(0); { const v4f l12 = GDN_L4(50, 12); __builtin_amdgcn_sched_barrier(0); x50 -= l12.x * x48; x50 -= l12.y * x49; } __builtin_amdgcn_sched_barrier(0);
        float x51 = GDN_RHS(51); { const v4f l0 = GDN_L4(51, 0); const v4f l1 = GDN_L4(51, 1); const v4f l2 = GDN_L4(51, 2); const v4f l3 = GDN_L4(51, 3); const v4f l4 = GDN_L4(51, 4); const v4f l5 = GDN_L4(51, 5); __builtin_amdgcn_sched_barrier(0); x51 -= l0.x * x0; x51 -= l0.y * x1; x51 -= l0.z * x2; x51 -= l0.w * x3; x51 -= l1.x * x4; x51 -= l1.y * x5; x51 -= l1.z * x6; x51 -= l1.w * x7; x51 -= l2.x * x8; x51 -= l2.y * x9; x51 -= l2.z * x10; x51 -= l2.w * x11; x51 -= l3.x * x12; x51 -= l3.y * x13; x51 -= l3.z * x14; x51 -= l3.w * x15; x51 -= l4.x * x16; x51 -= l4.y * x17; x51 -= l4.z * x18; x51 -= l4.w * x19; x51 -= l5.x * x20; x51 -= l5.y * x21; x51 -= l5.z * x22; x51 -= l5.w * x23; } __builtin_amdgcn_sched_barrier(0); { const v4f l6 = GDN_L4(51, 6); const v4f l7 = GDN_L4(51, 7); const v4f l8 = GDN_L4(51, 8); const v4f l9 = GDN_L4(51, 9); const v4f l10 = GDN_L4(51, 10); const v4f l11 = GDN_L4(51, 11); __builtin_amdgcn_sched_barrier(0); x51 -= l6.x * x24; x51 -= l6.y * x25; x51 -= l6.z * x26; x51 -= l6.w * x27; x51 -= l7.x * x28; x51 -= l7.y * x29; x51 -= l7.z * x30; x51 -= l7.w * x31; x51 -= l8.x * x32; x51 -= l8.y * x33; x51 -= l8.z * x34; x51 -= l8.w * x35; x51 -= l9.x * x36; x51 -= l9.y * x37; x51 -= l9.z * x38; x51 -= l9.w * x39; x51 -= l10.x * x40; x51 -= l10.y * x41; x51 -= l10.z * x42; x51 -= l10.w * x43; x51 -= l11.x * x44; x51 -= l11.y * x45; x51 -= l11.z * x46; x51 -= l11.w * x47; } __builtin_amdgcn_sched_barrier(0); { const v4f l12 = GDN_L4(51, 12); __builtin_amdgcn_sched_barrier(0); x51 -= l12.x * x48; x51 -= l12.y * x49; x51 -= l12.z * x50; } __builtin_amdgcn_sched_barrier(0);
        float x52 = GDN_RHS(52); { const v4f l0 = GDN_L4(52, 0); const v4f l1 = GDN_L4(52, 1); const v4f l2 = GDN_L4(52, 2); const v4f l3 = GDN_L4(52, 3); const v4f l4 = GDN_L4(52, 4); const v4f l5 = GDN_L4(52, 5); __builtin_amdgcn_sched_barrier(0); x52 -= l0.x * x0; x52 -= l0.y * x1; x52 -= l0.z * x2; x52 -= l0.w * x3; x52 -= l1.x * x4; x52 -= l1.y * x5; x52 -= l1.z * x6; x52 -= l1.w * x7; x52 -= l2.x * x8; x52 -= l2.y * x9; x52 -= l2.z * x10; x52 -= l2.w * x11; x52 -= l3.x * x12; x52 -= l3.y * x13; x52 -= l3.z * x14; x52 -= l3.w * x15; x52 -= l4.x * x16; x52 -= l4.y * x17; x52 -= l4.z * x18; x52 -= l4.w * x19; x52 -= l5.x * x20; x52 -= l5.y * x21; x52 -= l5.z * x22; x52 -= l5.w * x23; } __builtin_amdgcn_sched_barrier(0); { const v4f l6 = GDN_L4(52, 6); const v4f l7 = GDN_L4(52, 7); const v4f l8 = GDN_L4(52, 8); const v4f l9 = GDN_L4(52, 9); const v4f l10 = GDN_L4(52, 10); const v4f l11 = GDN_L4(52, 11); __builtin_amdgcn_sched_barrier(0); x52 -= l6.x * x24; x52 -= l6.y * x25; x52 -= l6.z * x26; x52 -= l6.w * x27; x52 -= l7.x * x28; x52 -= l7.y * x29; x52 -= l7.z * x30; x52 -= l7.w * x31; x52 -= l8.x * x32; x52 -= l8.y * x33; x52 -= l8.z * x34; x52 -= l8.w * x35; x52 -= l9.x * x36; x52 -= l9.y * x37; x52 -= l9.z * x38; x52 -= l9.w * x39; x52 -= l10.x * x40; x52 -= l10.y * x41; x52 -= l10.z * x42; x52 -= l10.w * x43; x52 -= l11.x * x44; x52 -= l11.y * x45; x52 -= l11.z * x46; x52 -= l11.w * x47; } __builtin_amdgcn_sched_barrier(0); { const v4f l12 = GDN_L4(52, 12); __builtin_amdgcn_sched_barrier(0); x52 -= l12.x * x48; x52 -= l12.y * x49; x52 -= l12.z * x50; x52 -= l12.w * x51; } __builtin_amdgcn_sched_barrier(0);
        float x53 = GDN_RHS(53); { const v4f l0 = GDN_L4(53, 0); const v4f l1 = GDN_L4(53, 1); const v4f l2 = GDN_L4(53, 2); const v4f l3 = GDN_L4(53, 3); const v4f l4 = GDN_L4(53, 4); const v4f l5 = GDN_L4(53, 5); __builtin_amdgcn_sched_barrier(0); x53 -= l0.x * x0; x53 -= l0.y * x1; x53 -= l0.z * x2; x53 -= l0.w * x3; x53 -= l1.x * x4; x53 -= l1.y * x5; x53 -= l1.z * x6; x53 -= l1.w * x7; x53 -= l2.x * x8; x53 -= l2.y * x9; x53 -= l2.z * x10; x53 -= l2.w * x11; x53 -= l3.x * x12; x53 -= l3.y * x13; x53 -= l3.z * x14; x53 -= l3.w * x15; x53 -= l4.x * x16; x53 -= l4.y * x17; x53 -= l4.z * x18; x53 -= l4.w * x19; x53 -= l5.x * x20; x53 -= l5.y * x21; x53 -= l5.z * x22; x53 -= l5.w * x23; } __builtin_amdgcn_sched_barrier(0); { const v4f l6 = GDN_L4(53, 6); const v4f l7 = GDN_L4(53, 7); const v4f l8 = GDN_L4(53, 8); const v4f l9 = GDN_L4(53, 9); const v4f l10 = GDN_L4(53, 10); const v4f l11 = GDN_L4(53, 11); __builtin_amdgcn_sched_barrier(0); x53 -= l6.x * x24; x53 -= l6.y * x25; x53 -= l6.z * x26; x53 -= l6.w * x27; x53 -= l7.x * x28; x53 -= l7.y * x29; x53 -= l7.z * x30; x53 -= l7.w * x31; x53 -= l8.x * x32; x53 -= l8.y * x33; x53 -= l8.z * x34; x53 -= l8.w * x35; x53 -= l9.x * x36; x53 -= l9.y * x37; x53 -= l9.z * x38; x53 -= l9.w * x39; x53 -= l10.x * x40; x53 -= l10.y * x41; x53 -= l10.z * x42; x53 -= l10.w * x43; x53 -= l11.x * x44; x53 -= l11.y * x45; x53 -= l11.z * x46; x53 -= l11.w * x47; } __builtin_amdgcn_sched_barrier(0); { const v4f l12 = GDN_L4(53, 12); const v4f l13 = GDN_L4(53, 13); __builtin_amdgcn_sched_barrier(0); x53 -= l12.x * x48; x53 -= l12.y * x49; x53 -= l12.z * x50; x53 -= l12.w * x51; x53 -= l13.x * x52; } __builtin_amdgcn_sched_barrier(0);
        float x54 = GDN_RHS(54); { const v4f l0 = GDN_L4(54, 0); const v4f l1 = GDN_L4(54, 1); const v4f l2 = GDN_L4(54, 2); const v4f l3 = GDN_L4(54, 3); const v4f l4 = GDN_L4(54, 4); const v4f l5 = GDN_L4(54, 5); __builtin_amdgcn_sched_barrier(0); x54 -= l0.x * x0; x54 -= l0.y * x1; x54 -= l0.z * x2; x54 -= l0.w * x3; x54 -= l1.x * x4; x54 -= l1.y * x5; x54 -= l1.z * x6; x54 -= l1.w * x7; x54 -= l2.x * x8; x54 -= l2.y * x9; x54 -= l2.z * x10; x54 -= l2.w * x11; x54 -= l3.x * x12; x54 -= l3.y * x13; x54 -= l3.z * x14; x54 -= l3.w * x15; x54 -= l4.x * x16; x54 -= l4.y * x17; x54 -= l4.z * x18; x54 -= l4.w * x19; x54 -= l5.x * x20; x54 -= l5.y * x21; x54 -= l5.z * x22; x54 -= l5.w * x23; } __builtin_amdgcn_sched_barrier(0); { const v4f l6 = GDN_L4(54, 6); const v4f l7 = GDN_L4(54, 7); const v4f l8 = GDN_L4(54, 8); const v4f l9 = GDN_L4(54, 9); const v4f l10 = GDN_L4(54, 10); const v4f l11 = GDN_L4(54, 11); __builtin_amdgcn_sched_barrier(0); x54 -= l6.x * x24; x54 -= l6.y * x25; x54 -= l6.z * x26; x54 -= l6.w * x27; x54 -= l7.x * x28; x54 -= l7.y * x29; x54 -= l7.z * x30; x54 -= l7.w * x31; x54 -= l8.x * x32; x54 -= l8.y * x33; x54 -= l8.z * x34; x54 -= l8.w * x35; x54 -= l9.x * x36; x54 -= l9.y * x37; x54 -= l9.z * x38; x54 -= l9.w * x39; x54 -= l10.x * x40; x54 -= l10.y * x41; x54 -= l10.z * x42; x54 -= l10.w * x43; x54 -= l11.x * x44; x54 -= l11.y * x45; x54 -= l11.z * x46; x54 -= l11.w * x47; } __builtin_amdgcn_sched_barrier(0); { const v4f l12 = GDN_L4(54, 12); const v4f l13 = GDN_L4(54, 13); __builtin_amdgcn_sched_barrier(0); x54 -= l12.x * x48; x54 -= l12.y * x49; x54 -= l12.z * x50; x54 -= l12.w * x51; x54 -= l13.x * x52; x54 -= l13.y * x53; } __builtin_amdgcn_sched_barrier(0);
        float x55 = GDN_RHS(55); { const v4f l0 = GDN_L4(55, 0); const v4f l1 = GDN_L4(55, 1); const v4f l2 = GDN_L4(55, 2); const v4f l3 = GDN_L4(55, 3); const v4f l4 = GDN_L4(55, 4); const v4f l5 = GDN_L4(55, 5); __builtin_amdgcn_sched_barrier(0); x55 -= l0.x * x0; x55 -= l0.y * x1; x55 -= l0.z * x2; x55 -= l0.w * x3; x55 -= l1.x * x4; x55 -= l1.y * x5; x55 -= l1.z * x6; x55 -= l1.w * x7; x55 -= l2.x * x8; x55 -= l2.y * x9; x55 -= l2.z * x10; x55 -= l2.w * x11; x55 -= l3.x * x12; x55 -= l3.y * x13; x55 -= l3.z * x14; x55 -= l3.w * x15; x55 -= l4.x * x16; x55 -= l4.y * x17; x55 -= l4.z * x18; x55 -= l4.w * x19; x55 -= l5.x * x20; x55 -= l5.y * x21; x55 -= l5.z * x22; x55 -= l5.w * x23; } __builtin_amdgcn_sched_barrier(0); { const v4f l6 = GDN_L4(55, 6); const v4f l7 = GDN_L4(55, 7); const v4f l8 = GDN_L4(55, 8); const v4f l9 = GDN_L4(55, 9); const v4f l10 = GDN_L4(55, 10); const v4f l11 = GDN_L4(55, 11); __builtin_amdgcn_sched_barrier(0); x55 -= l6.x * x24; x55 -= l6.y * x25; x55 -= l6.z * x26; x55 -= l6.w * x27; x55 -= l7.x * x28; x55 -= l7.y * x29; x55 -= l7.z * x30; x55 -= l7.w * x31; x55 -= l8.x * x32; x55 -= l8.y * x33; x55 -= l8.z * x34; x55 -= l8.w * x35; x55 -= l9.x * x36; x55 -= l9.y * x37; x55 -= l9.z * x38; x55 -= l9.w * x39; x55 -= l10.x * x40; x55 -= l10.y * x41; x55 -= l10.z * x42; x55 -= l10.w * x43; x55 -= l11.x * x44; x55 -= l11.y * x45; x55 -= l11.z * x46; x55 -= l11.w * x47; } __builtin_amdgcn_sched_barrier(0); { const v4f l12 = GDN_L4(55, 12); const v4f l13 = GDN_L4(55, 13); __builtin_amdgcn_sched_barrier(0); x55 -= l12.x * x48; x55 -= l12.y * x49; x55 -= l12.z * x50; x55 -= l12.w * x51; x55 -= l13.x * x52; x55 -= l13.y * x53; x55 -= l13.z * x54; } __builtin_amdgcn_sched_barrier(0);
        float x56 = GDN_RHS(56); { const v4f l0 = GDN_L4(56, 0); const v4f l1 = GDN_L4(56, 1); const v4f l2 = GDN_L4(56, 2); const v4f l3 = GDN_L4(56, 3); const v4f l4 = GDN_L4(56, 4); const v4f l5 = GDN_L4(56, 5); __builtin_amdgcn_sched_barrier(0); x56 -= l0.x * x0; x56 -= l0.y * x1; x56 -= l0.z * x2; x56 -= l0.w * x3; x56 -= l1.x * x4; x56 -= l1.y * x5; x56 -= l1.z * x6; x56 -= l1.w * x7; x56 -= l2.x * x8; x56 -= l2.y * x9; x56 -= l2.z * x10; x56 -= l2.w * x11; x56 -= l3.x * x12; x56 -= l3.y * x13; x56 -= l3.z * x14; x56 -= l3.w * x15; x56 -= l4.x * x16; x56 -= l4.y * x17; x56 -= l4.z * x18; x56 -= l4.w * x19; x56 -= l5.x * x20; x56 -= l5.y * x21; x56 -= l5.z * x22; x56 -= l5.w * x23; } __builtin_amdgcn_sched_barrier(0); { const v4f l6 = GDN_L4(56, 6); const v4f l7 = GDN_L4(56, 7); const v4f l8 = GDN_L4(56, 8); const v4f l9 = GDN_L4(56, 9); const v4f l10 = GDN_L4(56, 10); const v4f l11 = GDN_L4(56, 11); __builtin_amdgcn_sched_barrier(0); x56 -= l6.x * x24; x56 -= l6.y * x25; x56 -= l6.z * x26; x56 -= l6.w * x27; x56 -= l7.x * x28; x56 -= l7.y * x29; x56 -= l7.z * x30; x56 -= l7.w * x31; x56 -= l8.x * x32; x56 -= l8.y * x33; x56 -= l8.z * x34; x56 -= l8.w * x35; x56 -= l9.x * x36; x56 -= l9.y * x37; x56 -= l9.z * x38; x56 -= l9.w * x39; x56 -= l10.x * x40; x56 -= l10.y * x41; x56 -= l10.z * x42; x56 -= l10.w * x43; x56 -= l11.x * x44; x56 -= l11.y * x45; x56 -= l11.z * x46; x56 -= l11.w * x47; } __builtin_amdgcn_sched_barrier(0); { const v4f l12 = GDN_L4(56, 12); const v4f l13 = GDN_L4(56, 13); __builtin_amdgcn_sched_barrier(0); x56 -= l12.x * x48; x56 -= l12.y * x49; x56 -= l12.z * x50; x56 -= l12.w * x51; x56 -= l13.x * x52; x56 -= l13.y * x53; x56 -= l13.z * x54; x56 -= l13.w * x55; } __builtin_amdgcn_sched_barrier(0);
        float x57 = GDN_RHS(57); { const v4f l0 = GDN_L4(57, 0); const v4f l1 = GDN_L4(57, 1); const v4f l2 = GDN_L4(57, 2); const v4f l3 = GDN_L4(57, 3); const v4f l4 = GDN_L4(57, 4); const v4f l5 = GDN_L4(57, 5); __builtin_amdgcn_sched_barrier(0); x57 -= l0.x * x0; x57 -= l0.y * x1; x57 -= l0.z * x2; x57 -= l0.w * x3; x57 -= l1.x * x4; x57 -= l1.y * x5; x57 -= l1.z * x6; x57 -= l1.w * x7; x57 -= l2.x * x8; x57 -= l2.y * x9; x57 -= l2.z * x10; x57 -= l2.w * x11; x57 -= l3.x * x12; x57 -= l3.y * x13; x57 -= l3.z * x14; x57 -= l3.w * x15; x57 -= l4.x * x16; x57 -= l4.y * x17; x57 -= l4.z * x18; x57 -= l4.w * x19; x57 -= l5.x * x20; x57 -= l5.y * x21; x57 -= l5.z * x22; x57 -= l5.w * x23; } __builtin_amdgcn_sched_barrier(0); { const v4f l6 = GDN_L4(57, 6); const v4f l7 = GDN_L4(57, 7); const v4f l8 = GDN_L4(57, 8); const v4f l9 = GDN_L4(57, 9); const v4f l10 = GDN_L4(57, 10); const v4f l11 = GDN_L4(57, 11); __builtin_amdgcn_sched_barrier(0); x57 -= l6.x * x24; x57 -= l6.y * x25; x57 -= l6.z * x26; x57 -= l6.w * x27; x57 -= l7.x * x28; x57 -= l7.y * x29; x57 -= l7.z * x30; x57 -= l7.w * x31; x57 -= l8.x * x32; x57 -= l8.y * x33; x57 -= l8.z * x34; x57 -= l8.w * x35; x57 -= l9.x * x36; x57 -= l9.y * x37; x57 -= l9.z * x38; x57 -= l9.w * x39; x57 -= l10.x * x40; x57 -= l10.y * x41; x57 -= l10.z * x42; x57 -= l10.w * x43; x57 -= l11.x * x44; x57 -= l11.y * x45; x57 -= l11.z * x46; x57 -= l11.w * x47; } __builtin_amdgcn_sched_barrier(0); { const v4f l12 = GDN_L4(57, 12); const v4f l13 = GDN_L4(57, 13); const v4f l14 = GDN_L4(57, 14); __builtin_amdgcn_sched_barrier(0); x57 -= l12.x * x48; x57 -= l12.y * x49; x57 -= l12.z * x50; x57 -= l12.w * x51; x57 -= l13.x * x52; x57 -= l13.y * x53; x57 -= l13.z * x54; x57 -= l13.w * x55; x57 -= l14.x * x56; } __builtin_amdgcn_sched_barrier(0);
        float x58 = GDN_RHS(58); { const v4f l0 = GDN_L4(58, 0); const v4f l1 = GDN_L4(58, 1); const v4f l2 = GDN_L4(58, 2); const v4f l3 = GDN_L4(58, 3); const v4f l4 = GDN_L4(58, 4); const v4f l5 = GDN_L4(58, 5); __builtin_amdgcn_sched_barrier(0); x58 -= l0.x * x0; x58 -= l0.y * x1; x58 -= l0.z * x2; x58 -= l0.w * x3; x58 -= l1.x * x4; x58 -= l1.y * x5; x58 -= l1.z * x6; x58 -= l1.w * x7; x58 -= l2.x * x8; x58 -= l2.y * x9; x58 -= l2.z * x10; x58 -= l2.w * x11; x58 -= l3.x * x12; x58 -= l3.y * x13; x58 -= l3.z * x14; x58 -= l3.w * x15; x58 -= l4.x * x16; x58 -= l4.y * x17; x58 -= l4.z * x18; x58 -= l4.w * x19; x58 -= l5.x * x20; x58 -= l5.y * x21; x58 -= l5.z * x22; x58 -= l5.w * x23; } __builtin_amdgcn_sched_barrier(0); { const v4f l6 = GDN_L4(58, 6); const v4f l7 = GDN_L4(58, 7); const v4f l8 = GDN_L4(58, 8); const v4f l9 = GDN_L4(58, 9); const v4f l10 = GDN_L4(58, 10); const v4f l11 = GDN_L4(58, 11); __builtin_amdgcn_sched_barrier(0); x58 -= l6.x * x24; x58 -= l6.y * x25; x58 -= l6.z * x26; x58 -= l6.w * x27; x58 -= l7.x * x28; x58 -= l7.y * x29; x58 -= l7.z * x30; x58 -= l7.w * x31; x58 -= l8.x * x32; x58 -= l8.y * x33; x58 -= l8.z * x34; x58 -= l8.w * x35; x58 -= l9.x * x36; x58 -= l9.y * x37; x58 -= l9.z * x38; x58 -= l9.w * x39; x58 -= l10.x * x40; x58 -= l10.y * x41; x58 -= l10.z * x42; x58 -= l10.w * x43; x58 -= l11.x * x44; x58 -= l11.y * x45; x58 -= l11.z * x46; x58 -= l11.w * x47; } __builtin_amdgcn_sched_barrier(0); { const v4f l12 = GDN_L4(58, 12); const v4f l13 = GDN_L4(58, 13); const v4f l14 = GDN_L4(58, 14); __builtin_amdgcn_sched_barrier(0); x58 -= l12.x * x48; x58 -= l12.y * x49; x58 -= l12.z * x50; x58 -= l12.w * x51; x58 -= l13.x * x52; x58 -= l13.y * x53; x58 -= l13.z * x54; x58 -= l13.w * x55; x58 -= l14.x * x56; x58 -= l14.y * x57; } __builtin_amdgcn_sched_barrier(0);
        float x59 = GDN_RHS(59); { const v4f l0 = GDN_L4(59, 0); const v4f l1 = GDN_L4(59, 1); const v4f l2 = GDN_L4(59, 2); const v4f l3 = GDN_L4(59, 3); const v4f l4 = GDN_L4(59, 4); const v4f l5 = GDN_L4(59, 5); __builtin_amdgcn_sched_barrier(0); x59 -= l0.x * x0; x59 -= l0.y * x1; x59 -= l0.z * x2; x59 -= l0.w * x3; x59 -= l1.x * x4; x59 -= l1.y * x5; x59 -= l1.z * x6; x59 -= l1.w * x7; x59 -= l2.x * x8; x59 -= l2.y * x9; x59 -= l2.z * x10; x59 -= l2.w * x11; x59 -= l3.x * x12; x59 -= l3.y * x13; x59 -= l3.z * x14; x59 -= l3.w * x15; x59 -= l4.x * x16; x59 -= l4.y * x17; x59 -= l4.z * x18; x59 -= l4.w * x19; x59 -= l5.x * x20; x59 -= l5.y * x21; x59 -= l5.z * x22; x59 -= l5.w * x23; } __builtin_amdgcn_sched_barrier(0); { const v4f l6 = GDN_L4(59, 6); const v4f l7 = GDN_L4(59, 7); const v4f l8 = GDN_L4(59, 8); const v4f l9 = GDN_L4(59, 9); const v4f l10 = GDN_L4(59, 10); const v4f l11 = GDN_L4(59, 11); __builtin_amdgcn_sched_barrier(0); x59 -= l6.x * x24; x59 -= l6.y * x25; x59 -= l6.z * x26; x59 -= l6.w * x27; x59 -= l7.x * x28; x59 -= l7.y * x29; x59 -= l7.z * x30; x59 -= l7.w * x31; x59 -= l8.x * x32; x59 -= l8.y * x33; x59 -= l8.z * x34; x59 -= l8.w * x35; x59 -= l9.x * x36; x59 -= l9.y * x37; x59 -= l9.z * x38; x59 -= l9.w * x39; x59 -= l10.x * x40; x59 -= l10.y * x41; x59 -= l10.z * x42; x59 -= l10.w * x43; x59 -= l11.x * x44; x59 -= l11.y * x45; x59 -= l11.z * x46; x59 -= l11.w * x47; } __builtin_amdgcn_sched_barrier(0); { const v4f l12 = GDN_L4(59, 12); const v4f l13 = GDN_L4(59, 13); const v4f l14 = GDN_L4(59, 14); __builtin_amdgcn_sched_barrier(0); x59 -= l12.x * x48; x59 -= l12.y * x49; x59 -= l12.z * x50; x59 -= l12.w * x51; x59 -= l13.x * x52; x59 -= l13.y * x53; x59 -= l13.z * x54; x59 -= l13.w * x55; x59 -= l14.x * x56; x59 -= l14.y * x57; x59 -= l14.z * x58; } __builtin_amdgcn_sched_barrier(0);
        float x60 = GDN_RHS(60); { const v4f l0 = GDN_L4(60, 0); const v4f l1 = GDN_L4(60, 1); const v4f l2 = GDN_L4(60, 2); const v4f l3 = GDN_L4(60, 3); const v4f l4 = GDN_L4(60, 4); const v4f l5 = GDN_L4(60, 5); __builtin_amdgcn_sched_barrier(0); x60 -= l0.x * x0; x60 -= l0.y * x1; x60 -= l0.z * x2; x60 -= l0.w * x3; x60 -= l1.x * x4; x60 -= l1.y * x5; x60 -= l1.z * x6; x60 -= l1.w * x7; x60 -= l2.x * x8; x60 -= l2.y * x9; x60 -= l2.z * x10; x60 -= l2.w * x11; x60 -= l3.x * x12; x60 -= l3.y * x13; x60 -= l3.z * x14; x60 -= l3.w * x15; x60 -= l4.x * x16; x60 -= l4.y * x17; x60 -= l4.z * x18; x60 -= l4.w * x19; x60 -= l5.x * x20; x60 -= l5.y * x21; x60 -= l5.z * x22; x60 -= l5.w * x23; } __builtin_amdgcn_sched_barrier(0); { const v4f l6 = GDN_L4(60, 6); const v4f l7 = GDN_L4(60, 7); const v4f l8 = GDN_L4(60, 8); const v4f l9 = GDN_L4(60, 9); const v4f l10 = GDN_L4(60, 10); const v4f l11 = GDN_L4(60, 11); __builtin_amdgcn_sched_barrier(0); x60 -= l6.x * x24; x60 -= l6.y * x25; x60 -= l6.z * x26; x60 -= l6.w * x27; x60 -= l7.x * x28; x60 -= l7.y * x29; x60 -= l7.z * x30; x60 -= l7.w * x31; x60 -= l8.x * x32; x60 -= l8.y * x33; x60 -= l8.z * x34; x60 -= l8.w * x35; x60 -= l9.x * x36; x60 -= l9.y * x37; x60 -= l9.z * x38; x60 -= l9.w * x39; x60 -= l10.x * x40; x60 -= l10.y * x41; x60 -= l10.z * x42; x60 -= l10.w * x43; x60 -= l11.x * x44; x60 -= l11.y * x45; x60 -= l11.z * x46; x60 -= l11.w * x47; } __builtin_amdgcn_sched_barrier(0); { const v4f l12 = GDN_L4(60, 12); const v4f l13 = GDN_L4(60, 13); const v4f l14 = GDN_L4(60, 14); __builtin_amdgcn_sched_barrier(0); x60 -= l12.x * x48; x60 -= l12.y * x49; x60 -= l12.z * x50; x60 -= l12.w * x51; x60 -= l13.x * x52; x60 -= l13.y * x53; x60 -= l13.z * x54; x60 -= l13.w * x55; x60 -= l14.x * x56; x60 -= l14.y * x57; x60 -= l14.z * x58; x60 -= l14.w * x59; } __builtin_amdgcn_sched_barrier(0);
        float x61 = GDN_RHS(61); { const v4f l0 = GDN_L4(61, 0); const v4f l1 = GDN_L4(61, 1); const v4f l2 = GDN_L4(61, 2); const v4f l3 = GDN_L4(61, 3); const v4f l4 = GDN_L4(61, 4); const v4f l5 = GDN_L4(61, 5); __builtin_amdgcn_sched_barrier(0); x61 -= l0.x * x0; x61 -= l0.y * x1; x61 -= l0.z * x2; x61 -= l0.w * x3; x61 -= l1.x * x4; x61 -= l1.y * x5; x61 -= l1.z * x6; x61 -= l1.w * x7; x61 -= l2.x * x8; x61 -= l2.y * x9; x61 -= l2.z * x10; x61 -= l2.w * x11; x61 -= l3.x * x12; x61 -= l3.y * x13; x61 -= l3.z * x14; x61 -= l3.w * x15; x61 -= l4.x * x16; x61 -= l4.y * x17; x61 -= l4.z * x18; x61 -= l4.w * x19; x61 -= l5.x * x20; x61 -= l5.y * x21; x61 -= l5.z * x22; x61 -= l5.w * x23; } __builtin_amdgcn_sched_barrier(0); { const v4f l6 = GDN_L4(61, 6); const v4f l7 = GDN_L4(61, 7); const v4f l8 = GDN_L4(61, 8); const v4f l9 = GDN_L4(61, 9); const v4f l10 = GDN_L4(61, 10); const v4f l11 = GDN_L4(61, 11); __builtin_amdgcn_sched_barrier(0); x61 -= l6.x * x24; x61 -= l6.y * x25; x61 -= l6.z * x26; x61 -= l6.w * x27; x61 -= l7.x * x28; x61 -= l7.y * x29; x61 -= l7.z * x30; x61 -= l7.w * x31; x61 -= l8.x * x32; x61 -= l8.y * x33; x61 -= l8.z * x34; x61 -= l8.w * x35; x61 -= l9.x * x36; x61 -= l9.y * x37; x61 -= l9.z * x38; x61 -= l9.w * x39; x61 -= l10.x * x40; x61 -= l10.y * x41; x61 -= l10.z * x42; x61 -= l10.w * x43; x61 -= l11.x * x44; x61 -= l11.y * x45; x61 -= l11.z * x46; x61 -= l11.w * x47; } __builtin_amdgcn_sched_barrier(0); { const v4f l12 = GDN_L4(61, 12); const v4f l13 = GDN_L4(61, 13); const v4f l14 = GDN_L4(61, 14); const v4f l15 = GDN_L4(61, 15); __builtin_amdgcn_sched_barrier(0); x61 -= l12.x * x48; x61 -= l12.y * x49; x61 -= l12.z * x50; x61 -= l12.w * x51; x61 -= l13.x * x52; x61 -= l13.y * x53; x61 -= l13.z * x54; x61 -= l13.w * x55; x61 -= l14.x * x56; x61 -= l14.y * x57; x61 -= l14.z * x58; x61 -= l14.w * x59; x61 -= l15.x * x60; } __builtin_amdgcn_sched_barrier(0);
        float x62 = GDN_RHS(62); { const v4f l0 = GDN_L4(62, 0); const v4f l1 = GDN_L4(62, 1); const v4f l2 = GDN_L4(62, 2); const v4f l3 = GDN_L4(62, 3); const v4f l4 = GDN_L4(62, 4); const v4f l5 = GDN_L4(62, 5); __builtin_amdgcn_sched_barrier(0); x62 -= l0.x * x0; x62 -= l0.y * x1; x62 -= l0.z * x2; x62 -= l0.w * x3; x62 -= l1.x * x4; x62 -= l1.y * x5; x62 -= l1.z * x6; x62 -= l1.w * x7; x62 -= l2.x * x8; x62 -= l2.y * x9; x62 -= l2.z * x10; x62 -= l2.w * x11; x62 -= l3.x * x12; x62 -= l3.y * x13; x62 -= l3.z * x14; x62 -= l3.w * x15; x62 -= l4.x * x16; x62 -= l4.y * x17; x62 -= l4.z * x18; x62 -= l4.w * x19; x62 -= l5.x * x20; x62 -= l5.y * x21; x62 -= l5.z * x22; x62 -= l5.w * x23; } __builtin_amdgcn_sched_barrier(0); { const v4f l6 = GDN_L4(62, 6); const v4f l7 = GDN_L4(62, 7); const v4f l8 = GDN_L4(62, 8); const v4f l9 = GDN_L4(62, 9); const v4f l10 = GDN_L4(62, 10); const v4f l11 = GDN_L4(62, 11); __builtin_amdgcn_sched_barrier(0); x62 -= l6.x * x24; x62 -= l6.y * x25; x62 -= l6.z * x26; x62 -= l6.w * x27; x62 -= l7.x * x28; x62 -= l7.y * x29; x62 -= l7.z * x30; x62 -= l7.w * x31; x62 -= l8.x * x32; x62 -= l8.y * x33; x62 -= l8.z * x34; x62 -= l8.w * x35; x62 -= l9.x * x36; x62 -= l9.y * x37; x62 -= l9.z * x38; x62 -= l9.w * x39; x62 -= l10.x * x40; x62 -= l10.y * x41; x62 -= l10.z * x42; x62 -= l10.w * x43; x62 -= l11.x * x44; x62 -= l11.y * x45; x62 -= l11.z * x46; x62 -= l11.w * x47; } __builtin_amdgcn_sched_barrier(0); { const v4f l12 = GDN_L4(62, 12); const v4f l13 = GDN_L4(62, 13); const v4f l14 = GDN_L4(62, 14); const v4f l15 = GDN_L4(62, 15); __builtin_amdgcn_sched_barrier(0); x62 -= l12.x * x48; x62 -= l12.y * x49; x62 -= l12.z * x50; x62 -= l12.w * x51; x62 -= l13.x * x52; x62 -= l13.y * x53; x62 -= l13.z * x54; x62 -= l13.w * x55; x62 -= l14.x * x56; x62 -= l14.y * x57; x62 -= l14.z * x58; x62 -= l14.w * x59; x62 -= l15.x * x60; x62 -= l15.y * x61; } __builtin_amdgcn_sched_barrier(0);
        float x63 = GDN_RHS(63); { const v4f l0 = GDN_L4(63, 0); const v4f l1 = GDN_L4(63, 1); const v4f l2 = GDN_L4(63, 2); const v4f l3 = GDN_L4(63, 3); const v4f l4 = GDN_L4(63, 4); const v4f l5 = GDN_L4(63, 5); __builtin_amdgcn_sched_barrier(0); x63 -= l0.x * x0; x63 -= l0.y * x1; x63 -= l0.z * x2; x63 -= l0.w * x3; x63 -= l1.x * x4; x63 -= l1.y * x5; x63 -= l1.z * x6; x63 -= l1.w * x7; x63 -= l2.x * x8; x63 -= l2.y * x9; x63 -= l2.z * x10; x63 -= l2.w * x11; x63 -= l3.x * x12; x63 -= l3.y * x13; x63 -= l3.z * x14; x63 -= l3.w * x15; x63 -= l4.x * x16; x63 -= l4.y * x17; x63 -= l4.z * x18; x63 -= l4.w * x19; x63 -= l5.x * x20; x63 -= l5.y * x21; x63 -= l5.z * x22; x63 -= l5.w * x23; } __builtin_amdgcn_sched_barrier(0); { const v4f l6 = GDN_L4(63, 6); const v4f l7 = GDN_L4(63, 7); const v4f l8 = GDN_L4(63, 8); const v4f l9 = GDN_L4(63, 9); const v4f l10 = GDN_L4(63, 10); const v4f l11 = GDN_L4(63, 11); __builtin_amdgcn_sched_barrier(0); x63 -= l6.x * x24; x63 -= l6.y * x25; x63 -= l6.z * x26; x63 -= l6.w * x27; x63 -= l7.x * x28; x63 -= l7.y * x29; x63 -= l7.z * x30; x63 -= l7.w * x31; x63 -= l8.x * x32; x63 -= l8.y * x33; x63 -= l8.z * x34; x63 -= l8.w * x35; x63 -= l9.x * x36; x63 -= l9.y * x37; x63 -= l9.z * x38; x63 -= l9.w * x39; x63 -= l10.x * x40; x63 -= l10.y * x41; x63 -= l10.z * x42; x63 -= l10.w * x43; x63 -= l11.x * x44; x63 -= l11.y * x45; x63 -= l11.z * x46; x63 -= l11.w * x47; } __builtin_amdgcn_sched_barrier(0); { const v4f l12 = GDN_L4(63, 12); const v4f l13 = GDN_L4(63, 13); const v4f l14 = GDN_L4(63, 14); const v4f l15 = GDN_L4(63, 15); __builtin_amdgcn_sched_barrier(0); x63 -= l12.x * x48; x63 -= l12.y * x49; x63 -= l12.z * x50; x63 -= l12.w * x51; x63 -= l13.x * x52; x63 -= l13.y * x53; x63 -= l13.z * x54; x63 -= l13.w * x55; x63 -= l14.x * x56; x63 -= l14.y * x57; x63 -= l14.z * x58; x63 -= l14.w * x59; x63 -= l15.x * x60; x63 -= l15.y * x61; x63 -= l15.z * x62; } __builtin_amdgcn_sched_barrier(0);
        if (c < 128) { GU[0 * 128 + c] = x0; GU[1 * 128 + c] = x1; GU[2 * 128 + c] = x2; GU[3 * 128 + c] = x3; GU[4 * 128 + c] = x4; GU[5 * 128 + c] = x5; GU[6 * 128 + c] = x6; GU[7 * 128 + c] = x7; GU[8 * 128 + c] = x8; GU[9 * 128 + c] = x9; GU[10 * 128 + c] = x10; GU[11 * 128 + c] = x11; GU[12 * 128 + c] = x12; GU[13 * 128 + c] = x13; GU[14 * 128 + c] = x14; GU[15 * 128 + c] = x15; GU[16 * 128 + c] = x16; GU[17 * 128 + c] = x17; GU[18 * 128 + c] = x18; GU[19 * 128 + c] = x19; GU[20 * 128 + c] = x20; GU[21 * 128 + c] = x21; GU[22 * 128 + c] = x22; GU[23 * 128 + c] = x23; GU[24 * 128 + c] = x24; GU[25 * 128 + c] = x25; GU[26 * 128 + c] = x26; GU[27 * 128 + c] = x27; GU[28 * 128 + c] = x28; GU[29 * 128 + c] = x29; GU[30 * 128 + c] = x30; GU[31 * 128 + c] = x31; GU[32 * 128 + c] = x32; GU[33 * 128 + c] = x33; GU[34 * 128 + c] = x34; GU[35 * 128 + c] = x35; GU[36 * 128 + c] = x36; GU[37 * 128 + c] = x37; GU[38 * 128 + c] = x38; GU[39 * 128 + c] = x39; GU[40 * 128 + c] = x40; GU[41 * 128 + c] = x41; GU[42 * 128 + c] = x42; GU[43 * 128 + c] = x43; GU[44 * 128 + c] = x44; GU[45 * 128 + c] = x45; GU[46 * 128 + c] = x46; GU[47 * 128 + c] = x47; GU[48 * 128 + c] = x48; GU[49 * 128 + c] = x49; GU[50 * 128 + c] = x50; GU[51 * 128 + c] = x51; GU[52 * 128 + c] = x52; GU[53 * 128 + c] = x53; GU[54 * 128 + c] = x54; GU[55 * 128 + c] = x55; GU[56 * 128 + c] = x56; GU[57 * 128 + c] = x57; GU[58 * 128 + c] = x58; GU[59 * 128 + c] = x59; GU[60 * 128 + c] = x60; GU[61 * 128 + c] = x61; GU[62 * 128 + c] = x62; GU[63 * 128 + c] = x63; }
        else { GNW[0 * 128 + (c - 128)] = (bf16)f2bf(-x0); GNW[1 * 128 + (c - 128)] = (bf16)f2bf(-x1); GNW[2 * 128 + (c - 128)] = (bf16)f2bf(-x2); GNW[3 * 128 + (c - 128)] = (bf16)f2bf(-x3); GNW[4 * 128 + (c - 128)] = (bf16)f2bf(-x4); GNW[5 * 128 + (c - 128)] = (bf16)f2bf(-x5); GNW[6 * 128 + (c - 128)] = (bf16)f2bf(-x6); GNW[7 * 128 + (c - 128)] = (bf16)f2bf(-x7); GNW[8 * 128 + (c - 128)] = (bf16)f2bf(-x8); GNW[9 * 128 + (c - 128)] = (bf16)f2bf(-x9); GNW[10 * 128 + (c - 128)] = (bf16)f2bf(-x10); GNW[11 * 128 + (c - 128)] = (bf16)f2bf(-x11); GNW[12 * 128 + (c - 128)] = (bf16)f2bf(-x12); GNW[13 * 128 + (c - 128)] = (bf16)f2bf(-x13); GNW[14 * 128 + (c - 128)] = (bf16)f2bf(-x14); GNW[15 * 128 + (c - 128)] = (bf16)f2bf(-x15); GNW[16 * 128 + (c - 128)] = (bf16)f2bf(-x16); GNW[17 * 128 + (c - 128)] = (bf16)f2bf(-x17); GNW[18 * 128 + (c - 128)] = (bf16)f2bf(-x18); GNW[19 * 128 + (c - 128)] = (bf16)f2bf(-x19); GNW[20 * 128 + (c - 128)] = (bf16)f2bf(-x20); GNW[21 * 128 + (c - 128)] = (bf16)f2bf(-x21); GNW[22 * 128 + (c - 128)] = (bf16)f2bf(-x22); GNW[23 * 128 + (c - 128)] = (bf16)f2bf(-x23); GNW[24 * 128 + (c - 128)] = (bf16)f2bf(-x24); GNW[25 * 128 + (c - 128)] = (bf16)f2bf(-x25); GNW[26 * 128 + (c - 128)] = (bf16)f2bf(-x26); GNW[27 * 128 + (c - 128)] = (bf16)f2bf(-x27); GNW[28 * 128 + (c - 128)] = (bf16)f2bf(-x28); GNW[29 * 128 + (c - 128)] = (bf16)f2bf(-x29); GNW[30 * 128 + (c - 128)] = (bf16)f2bf(-x30); GNW[31 * 128 + (c - 128)] = (bf16)f2bf(-x31); GNW[32 * 128 + (c - 128)] = (bf16)f2bf(-x32); GNW[33 * 128 + (c - 128)] = (bf16)f2bf(-x33); GNW[34 * 128 + (c - 128)] = (bf16)f2bf(-x34); GNW[35 * 128 + (c - 128)] = (bf16)f2bf(-x35); GNW[36 * 128 + (c - 128)] = (bf16)f2bf(-x36); GNW[37 * 128 + (c - 128)] = (bf16)f2bf(-x37); GNW[38 * 128 + (c - 128)] = (bf16)f2bf(-x38); GNW[39 * 128 + (c - 128)] = (bf16)f2bf(-x39); GNW[40 * 128 + (c - 128)] = (bf16)f2bf(-x40); GNW[41 * 128 + (c - 128)] = (bf16)f2bf(-x41); GNW[42 * 128 + (c - 128)] = (bf16)f2bf(-x42); GNW[43 * 128 + (c - 128)] = (bf16)f2bf(-x43); GNW[44 * 128 + (c - 128)] = (bf16)f2bf(-x44); GNW[45 * 128 + (c - 128)] = (bf16)f2bf(-x45); GNW[46 * 128 + (c - 128)] = (bf16)f2bf(-x46); GNW[47 * 128 + (c - 128)] = (bf16)f2bf(-x47); GNW[48 * 128 + (c - 128)] = (bf16)f2bf(-x48); GNW[49 * 128 + (c - 128)] = (bf16)f2bf(-x49); GNW[50 * 128 + (c - 128)] = (bf16)f2bf(-x50); GNW[51 * 128 + (c - 128)] = (bf16)f2bf(-x51); GNW[52 * 128 + (c - 128)] = (bf16)f2bf(-x52); GNW[53 * 128 + (c - 128)] = (bf16)f2bf(-x53); GNW[54 * 128 + (c - 128)] = (bf16)f2bf(-x54); GNW[55 * 128 + (c - 128)] = (bf16)f2bf(-x55); GNW[56 * 128 + (c - 128)] = (bf16)f2bf(-x56); GNW[57 * 128 + (c - 128)] = (bf16)f2bf(-x57); GNW[58 * 128 + (c - 128)] = (bf16)f2bf(-x58); GNW[59 * 128 + (c - 128)] = (bf16)f2bf(-x59); GNW[60 * 128 + (c - 128)] = (bf16)f2bf(-x60); GNW[61 * 128 + (c - 128)] = (bf16)f2bf(-x61); GNW[62 * 128 + (c - 128)] = (bf16)f2bf(-x62); GNW[63 * 128 + (c - 128)] = (bf16)f2bf(-x63); }
#undef GDN_RHS
#undef GDN_L4
    } else {
        const int t2 = tid - 256; const float gl = gcs[63];
        { const int i = t2 >> 2, d0 = (t2 & 3) * 32; const float e = __expf(gcs[i]);
#pragma unroll
          for (int x8 = 0; x8 < 4; ++x8) { const v4f a = *(const LAS v4f*)(qs + i * QP + d0 + 8 * x8), b = *(const LAS v4f*)(qs + i * QP + d0 + 8 * x8 + 4);
              v4u w; w.x = pk2(a.x * e, a.y * e); w.y = pk2(a.z * e, a.w * e); w.z = pk2(b.x * e, b.y * e); w.w = pk2(b.z * e, b.w * e); *(v4u*)(GQG + i * 128 + d0 + 8 * x8) = w; } }
        { const int d = t2 >> 1, j0 = (t2 & 1) * 32;
#pragma unroll
          for (int x8 = 0; x8 < 4; ++x8) { float o[8];
#pragma unroll
              for (int x = 0; x < 8; ++x) { const int j = j0 + 8 * x8 + x; o[x] = ks[j * QP + d] * __expf(gl - gcs[j]); }
              v4u w; w.x = pk2(o[0], o[1]); w.y = pk2(o[2], o[3]); w.z = pk2(o[4], o[5]); w.w = pk2(o[6], o[7]); *(v4u*)(GKT + d * 64 + j0 + 8 * x8) = w; } }
        if (t2 == 0) GDL[item] = __expf(gl);
    }
    __syncthreads();
}
struct GdnFrags { bf16x8_t nw[4], qg[4], at[2], kt[2][2]; float u[4]; float dl; };
__device__ __forceinline__ void gdn_load(GdnFrags& F, const Params& p, int item, int off128, int off64, int offk, int offu) {
    const bf16* GNW = (const bf16*)(p.ws + WS_GNW) + (size_t)item * 8192; const bf16* GQG = (const bf16*)(p.ws + WS_GQG) + (size_t)item * 8192;
    const bf16* GAT = (const bf16*)(p.ws + WS_GAT) + (size_t)item * 4096; const bf16* GKT = (const bf16*)(p.ws + WS_GKT) + (size_t)item * 8192; const float* GU = (const float*)(p.ws + WS_GU) + (size_t)item * 8192;
#pragma unroll
    for (int ks = 0; ks < 4; ++ks) { F.nw[ks] = *(const bf16x8_t*)(GNW + off128 + 32 * ks); F.qg[ks] = *(const bf16x8_t*)(GQG + off128 + 32 * ks); }
#pragma unroll
    for (int ks = 0; ks < 2; ++ks) { F.at[ks] = *(const bf16x8_t*)(GAT + off64 + 32 * ks); F.kt[0][ks] = *(const bf16x8_t*)(GKT + offk + 32 * ks); F.kt[1][ks] = *(const bf16x8_t*)(GKT + offk + 1024 + 32 * ks); }
#pragma unroll
    for (int r = 0; r < 4; ++r) F.u[r] = GU[offu + r * 128];
    F.dl = ((const float*)(p.ws + WS_GDL))[item];
}
constexpr int STP = 136, VNP = 72;
__device__ __forceinline__ void gdn_seq(const Params& p, LAS unsigned char* lds, int wgi, int wave, int lane) {
    const int u = wgi * 2 + (wave >> 2), wi = wave & 3, h = u >> 3, sl = u & 7, g = lane >> 4, c = lane & 15;
    LAS unsigned short* ST = (LAS unsigned short*)(lds + (wave >> 2) * 12288);
    LAS unsigned short* VNT = ST + 2 * 16 * STP;
    float* GO = (float*)(p.ws + WS_GO);
    const int off128 = (16 * wi + c) * 128 + 8 * g, off64 = (16 * wi + c) * 64 + 8 * g, offk = (32 * wi + c) * 64 + 8 * g, offu = (16 * wi + 4 * g) * 128 + 16 * sl + c;
#pragma unroll
    for (int mt = 0; mt < 2; ++mt) *(LAS v2u*)(ST + c * STP + 16 * (2 * wi + mt) + 4 * g) = (v2u){0u, 0u};
    pg8::f32x4 Sacc[2] = {{0.f, 0.f, 0.f, 0.f}, {0.f, 0.f, 0.f, 0.f}};
    __syncthreads();
    GdnFrags F0, F1;
    gdn_load(F0, p, h, off128, off64, offk, offu);
#define GDN_STEP(F, n_) do { const int cur = (n_) & 1; bf16x8_t sf[4]; \
        _Pragma("unroll") for (int ks = 0; ks < 4; ++ks) sf[ks] = *(const LAS bf16x8_t*)(ST + cur * 16 * STP + c * STP + 32 * ks + 8 * g); \
        pg8::f32x4 vn = {F.u[0], F.u[1], F.u[2], F.u[3]}; \
        _Pragma("unroll") for (int ks = 0; ks < 4; ++ks) vn = __builtin_amdgcn_mfma_f32_16x16x32_bf16(F.nw[ks], sf[ks], vn, 0, 0, 0); \
        { v2u w; w.x = pk2(vn[0], vn[1]); w.y = pk2(vn[2], vn[3]); *(LAS v2u*)(VNT + c * VNP + 16 * wi + 4 * g) = w; } \
        LDS_BAR(); \
        const bf16x8_t v0 = *(const LAS bf16x8_t*)(VNT + c * VNP + 8 * g), v1 = *(const LAS bf16x8_t*)(VNT + c * VNP + 32 + 8 * g); \
        pg8::f32x4 o = {0.f, 0.f, 0.f, 0.f}; \
        _Pragma("unroll") for (int ks = 0; ks < 4; ++ks) o = __builtin_amdgcn_mfma_f32_16x16x32_bf16(F.qg[ks], sf[ks], o, 0, 0, 0); \
        o = __builtin_amdgcn_mfma_f32_16x16x32_bf16(F.at[0], v0, o, 0, 0, 0); o = __builtin_amdgcn_mfma_f32_16x16x32_bf16(F.at[1], v1, o, 0, 0, 0); \
        { const size_t tb = (size_t)(n_) * 64 + 16 * wi + 4 * g; _Pragma("unroll") for (int r = 0; r < 4; ++r) GO[(tb + r) * BW + h * 128 + 16 * sl + c] = o[r]; } \
        _Pragma("unroll") for (int mt = 0; mt < 2; ++mt) { Sacc[mt] = Sacc[mt] * F.dl; \
            Sacc[mt] = __builtin_amdgcn_mfma_f32_16x16x32_bf16(F.kt[mt][0], v0, Sacc[mt], 0, 0, 0); Sacc[mt] = __builtin_amdgcn_mfma_f32_16x16x32_bf16(F.kt[mt][1], v1, Sacc[mt], 0, 0, 0); \
            v2u w; w.x = pk2(Sacc[mt][0], Sacc[mt][1]); w.y = pk2(Sacc[mt][2], Sacc[mt][3]); *(LAS v2u*)(ST + (cur ^ 1) * 16 * STP + c * STP + 16 * (2 * wi + mt) + 4 * g) = w; } \
        LDS_BAR(); } while (0)
    for (int n = 0; n < T / 64; n += 2) {
        gdn_load(F1, p, (n + 1) * 4 + h, off128, off64, offk, offu);
        GDN_STEP(F0, n);
        gdn_load(F0, p, ((n + 2 < T / 64) ? n + 2 : n) * 4 + h, off128, off64, offk, offu);
        GDN_STEP(F1, n + 1);
    }
#undef GDN_STEP
}

constexpr int SEQ_UOFF = 132096;
constexpr int GI_NW = 0, GI_QG = 8704, GI_AT = 17408, GI_KT = 22016, GI_SZ = 31232;
struct GdnStage { v4u r[7]; float u[4]; float dl; };
__device__ __forceinline__ void gdn_stage_load(GdnStage& Sg, const Params& p, int item, int tid, int offu) {
    const bf16* GNW = (const bf16*)(p.ws + WS_GNW) + (size_t)item * 8192; const bf16* GQG = (const bf16*)(p.ws + WS_GQG) + (size_t)item * 8192;
    const bf16* GAT = (const bf16*)(p.ws + WS_GAT) + (size_t)item * 4096; const bf16* GKT = (const bf16*)(p.ws + WS_GKT) + (size_t)item * 8192; const float* GU = (const float*)(p.ws + WS_GU) + (size_t)item * 8192;
    Sg.r[0] = *(const v4u*)(GNW + 8 * tid); Sg.r[1] = *(const v4u*)(GNW + 8 * (tid + 512)); Sg.r[2] = *(const v4u*)(GQG + 8 * tid); Sg.r[3] = *(const v4u*)(GQG + 8 * (tid + 512));
    Sg.r[4] = *(const v4u*)(GAT + 8 * tid); Sg.r[5] = *(const v4u*)(GKT + 8 * tid); Sg.r[6] = *(const v4u*)(GKT + 8 * (tid + 512));
#pragma unroll
    for (int r = 0; r < 4; ++r) Sg.u[r] = GU[offu + r * 128];
    Sg.dl = ((const float*)(p.ws + WS_GDL))[item];
}
__device__ __forceinline__ void gdn_stage_write(const GdnStage& Sg, LAS unsigned short* img, int tid) {
    { const int p0 = tid, p1 = tid + 512;
      *(LAS v4u*)(img + GI_NW + (p0 >> 4) * 136 + 8 * (p0 & 15)) = Sg.r[0]; *(LAS v4u*)(img + GI_NW + (p1 >> 4) * 136 + 8 * (p1 & 15)) = Sg.r[1];
      *(LAS v4u*)(img + GI_QG + (p0 >> 4) * 136 + 8 * (p0 & 15)) = Sg.r[2]; *(LAS v4u*)(img + GI_QG + (p1 >> 4) * 136 + 8 * (p1 & 15)) = Sg.r[3];
      *(LAS v4u*)(img + GI_AT + (p0 >> 3) * 72 + 8 * (p0 & 7)) = Sg.r[4];
      *(LAS v4u*)(img + GI_KT + (p0 >> 3) * 72 + 8 * (p0 & 7)) = Sg.r[5]; *(LAS v4u*)(img + GI_KT + (p1 >> 3) * 72 + 8 * (p1 & 7)) = Sg.r[6]; }
}
__device__ __forceinline__ void gdn_seq2(const Params& p, LAS unsigned char* lds, int wgi, int tid, int wave, int lane) {
    const int h = wgi >> 2, sl = 2 * (wgi & 3) + (wave >> 2), wi = wave & 3, g = lane >> 4, c = lane & 15;
    LAS unsigned short* IMG = (LAS unsigned short*)lds;
    LAS unsigned short* ST = (LAS unsigned short*)(lds + SEQ_UOFF + (wave >> 2) * 12288);
    LAS unsigned short* VNT = ST + 2 * 16 * STP;
    float* GO = (float*)(p.ws + WS_GO);
    const int offu = (16 * wi + 4 * g) * 128 + 16 * sl + c;
#pragma unroll
    for (int mt = 0; mt < 2; ++mt) *(LAS v2u*)(ST + c * STP + 16 * (2 * wi + mt) + 4 * g) = (v2u){0u, 0u};
    pg8::f32x4 Sacc[2] = {{0.f, 0.f, 0.f, 0.f}, {0.f, 0.f, 0.f, 0.f}};
    GdnStage A, B;
    gdn_stage_load(A, p, h, tid, offu); gdn_stage_write(A, IMG, tid);
    gdn_stage_load(B, p, 4 + h, tid, offu);
    LDS_BAR();
    constexpr int NCH = T / 64;
#define GDN_STEP2(X, Y, n_) do { const int cur = (n_) & 1; const LAS unsigned short* im = IMG + cur * GI_SZ; bf16x8_t sf[4]; \
        _Pragma("unroll") for (int ks = 0; ks < 4; ++ks) sf[ks] = *(const LAS bf16x8_t*)(ST + cur * 16 * STP + c * STP + 32 * ks + 8 * g); \
        pg8::f32x4 vn = {X.u[0], X.u[1], X.u[2], X.u[3]}; const float dl = X.dl; \
        _Pragma("unroll") for (int ks = 0; ks < 4; ++ks) vn = __builtin_amdgcn_mfma_f32_16x16x32_bf16(*(const LAS bf16x8_t*)(im + GI_NW + (16 * wi + c) * 136 + 32 * ks + 8 * g), sf[ks], vn, 0, 0, 0); \
        { v2u w; w.x = pk2(vn[0], vn[1]); w.y = pk2(vn[2], vn[3]); *(LAS v2u*)(VNT + c * VNP + 16 * wi + 4 * g) = w; } \
        pg8::f32x4 o = {0.f, 0.f, 0.f, 0.f}; \
        _Pragma("unroll") for (int ks = 0; ks < 4; ++ks) o = __builtin_amdgcn_mfma_f32_16x16x32_bf16(*(const LAS bf16x8_t*)(im + GI_QG + (16 * wi + c) * 136 + 32 * ks + 8 * g), sf[ks], o, 0, 0, 0); \
        LDS_BAR(); \
        gdn_stage_load(X, p, (((n_) + 2 < NCH) ? (n_) + 2 : (n_)) * 4 + h, tid, offu); \
        const bf16x8_t v0 = *(const LAS bf16x8_t*)(VNT + c * VNP + 8 * g), v1 = *(const LAS bf16x8_t*)(VNT + c * VNP + 32 + 8 * g); \
        o = __builtin_amdgcn_mfma_f32_16x16x32_bf16(*(const LAS bf16x8_t*)(im + GI_AT + (16 * wi + c) * 72 + 8 * g), v0, o, 0, 0, 0); \
        o = __builtin_amdgcn_mfma_f32_16x16x32_bf16(*(const LAS bf16x8_t*)(im + GI_AT + (16 * wi + c) * 72 + 32 + 8 * g), v1, o, 0, 0, 0); \
        { const size_t tb = (size_t)(n_) * 64 + 16 * wi + 4 * g; _Pragma("unroll") for (int r = 0; r < 4; ++r) GO[(tb + r) * BW + h * 128 + 16 * sl + c] = o[r]; } \
        _Pragma("unroll") for (int mt = 0; mt < 2; ++mt) { Sacc[mt] = Sacc[mt] * dl; \
            Sacc[mt] = __builtin_amdgcn_mfma_f32_16x16x32_bf16(*(const LAS bf16x8_t*)(im + GI_KT + (16 * (2 * wi + mt) + c) * 72 + 8 * g), v0, Sacc[mt], 0, 0, 0); \
            Sacc[mt] = __builtin_amdgcn_mfma_f32_16x16x32_bf16(*(const LAS bf16x8_t*)(im + GI_KT + (16 * (2 * wi + mt) + c) * 72 + 32 + 8 * g), v1, Sacc[mt], 0, 0, 0); \
            v2u w; w.x = pk2(Sacc[mt][0], Sacc[mt][1]); w.y = pk2(Sacc[mt][2], Sacc[mt][3]); *(LAS v2u*)(ST + (cur ^ 1) * 16 * STP + c * STP + 16 * (2 * wi + mt) + 4 * g) = w; } \
        gdn_stage_write(Y, IMG + (cur ^ 1) * GI_SZ, tid); \
        LDS_BAR(); } while (0)
    for (int n = 0; n < NCH; n += 2) { GDN_STEP2(A, B, n); GDN_STEP2(B, A, n + 1); }
#undef GDN_STEP2
}
constexpr int MI_Q = 0, MI_S = 4608, MI_K = 9216, MI_SZ = 13824;
struct MlStage { v4u r[3]; bf16x8_t vt[2]; float fl; };
__device__ __forceinline__ void ml_stage_load(MlStage& Sg, const Params& p, int item, int tid, int offV) {
    const bf16* MQ = (const bf16*)(p.ws + WS_MQ) + (size_t)item * 4096; const bf16* MS = (const bf16*)(p.ws + WS_MS) + (size_t)item * 4096; const bf16* MK = (const bf16*)(p.ws + WS_MK) + (size_t)item * 4096;
    const bf16* MV = (const bf16*)(p.ws + WS_MV) + (size_t)item * 9216;
    Sg.r[0] = *(const v4u*)(MQ + 8 * tid); Sg.r[1] = *(const v4u*)(MS + 8 * tid); Sg.r[2] = *(const v4u*)(MK + 8 * tid);
    Sg.vt[0] = *(const bf16x8_t*)(MV + offV); Sg.vt[1] = *(const bf16x8_t*)(MV + offV + 32);
    Sg.fl = ((const float*)(p.ws + WS_MFL))[item];
}
__device__ __forceinline__ void ml_stage_write(const MlStage& Sg, LAS unsigned short* img, int tid) {
    const int o = (tid >> 3) * 72 + 8 * (tid & 7);
    *(LAS v4u*)(img + MI_Q + o) = Sg.r[0]; *(LAS v4u*)(img + MI_S + o) = Sg.r[1]; *(LAS v4u*)(img + MI_K + o) = Sg.r[2];
}
__device__ __forceinline__ void ml_seq2(const Params& p, LAS unsigned char* lds, int wgi, int tid, int wave, int lane) {
    const int h = wgi / 5, sl0 = 2 * (wgi % 5) + (wave >> 2), wi = wave & 3, g = lane >> 4, c = lane & 15;
    const bool real = sl0 < 9; const int sl = real ? sl0 : 8;
    LAS unsigned short* IMG = (LAS unsigned short*)lds;
    LAS unsigned short* CT = (LAS unsigned short*)(lds + SEQ_UOFF + (wave >> 2) * 8192);
    float* HO = (float*)(p.ws + WS_HO); float* HDEN = (float*)(p.ws + WS_HDEN);
    const int offV = (16 * sl + c) * 64 + 8 * g;
    *(LAS v2u*)(CT + c * 72 + 16 * wi + 4 * g) = (v2u){0u, 0u};
    pg8::f32x4 Cacc = {0.f, 0.f, 0.f, 0.f};
    MlStage A, B;
    ml_stage_load(A, p, h, tid, offV); ml_stage_write(A, IMG, tid);
    ml_stage_load(B, p, 4 + h, tid, offV);
    LDS_BAR();
    constexpr int NCH = T / 64;
#define ML_STEP2(X, Y, n_) do { const int cur = (n_) & 1; const LAS unsigned short* im = IMG + cur * MI_SZ; const int ro = (16 * wi + c) * 72 + 8 * g; \
        const bf16x8_t c0 = *(const LAS bf16x8_t*)(CT + cur * 16 * 72 + c * 72 + 8 * g), c1 = *(const LAS bf16x8_t*)(CT + cur * 16 * 72 + c * 72 + 32 + 8 * g); \
        const bf16x8_t vt0 = X.vt[0], vt1 = X.vt[1]; const float fl = X.fl; \
        pg8::f32x4 num = {0.f, 0.f, 0.f, 0.f}; \
        num = __builtin_amdgcn_mfma_f32_16x16x32_bf16(*(const LAS bf16x8_t*)(im + MI_Q + ro), c0, num, 0, 0, 0); num = __builtin_amdgcn_mfma_f32_16x16x32_bf16(*(const LAS bf16x8_t*)(im + MI_Q + ro + 32), c1, num, 0, 0, 0); \
        num = __builtin_amdgcn_mfma_f32_16x16x32_bf16(*(const LAS bf16x8_t*)(im + MI_S + ro), vt0, num, 0, 0, 0); num = __builtin_amdgcn_mfma_f32_16x16x32_bf16(*(const LAS bf16x8_t*)(im + MI_S + ro + 32), vt1, num, 0, 0, 0); \
        Cacc = Cacc * fl; \
        Cacc = __builtin_amdgcn_mfma_f32_16x16x32_bf16(*(const LAS bf16x8_t*)(im + MI_K + ro), vt0, Cacc, 0, 0, 0); Cacc = __builtin_amdgcn_mfma_f32_16x16x32_bf16(*(const LAS bf16x8_t*)(im + MI_K + ro + 32), vt1, Cacc, 0, 0, 0); \
        ml_stage_load(X, p, (((n_) + 2 < NCH) ? (n_) + 2 : (n_)) * 4 + h, tid, offV); \
        { v2u w; w.x = pk2(Cacc[0], Cacc[1]); w.y = pk2(Cacc[2], Cacc[3]); *(LAS v2u*)(CT + (cur ^ 1) * 16 * 72 + c * 72 + 16 * wi + 4 * g) = w; } \
        { const size_t tb = (size_t)(n_) * 64 + 16 * wi + 4 * g; \
          if (sl < 8) { _Pragma("unroll") for (int r = 0; r < 4; ++r) HO[(tb + r) * BW + h * 128 + 16 * sl + c] = num[r]; } \
          else if (c == 0 && real) { _Pragma("unroll") for (int r = 0; r < 4; ++r) HDEN[(tb + r) * 4 + h] = num[r]; } } \
        ml_stage_write(Y, IMG + (cur ^ 1) * MI_SZ, tid); \
        LDS_BAR(); } while (0)
    for (int n = 0; n < NCH; n += 2) { ML_STEP2(A, B, n); ML_STEP2(B, A, n + 1); }
#undef ML_STEP2
}

__device__ __forceinline__ void mixer_gmlp_item(const Params& p, int l, LAS unsigned char* lds, int item, int tid, int wave, int lane) {
    const int chunk = item >> 1, hf = item & 1; const size_t tok0 = (size_t)chunk * 128;
    const bf16* Z = (const bf16*)(p.ws + WS_Z);
    const float* ng = p.in[I_GMNG] + l * BW; const float* nb = p.in[I_GMNB] + l * BW;
    LAS unsigned short* vT = (LAS unsigned short*)lds;
    {   v4u raw[16];
#pragma unroll
        for (int r = 0; r < 16; ++r) raw[r] = *(const v4u*)(Z + (tok0 + wave * 16 + r) * ZC + ZC_GMV + 8 * lane);
        float gn[8], gb[8];
#pragma unroll
        for (int i = 0; i < 8; ++i) { gn[i] = ng[8 * lane + i]; gb[i] = nb[8 * lane + i]; }
#pragma unroll
        for (int r = 0; r < 16; ++r) { const int tk = wave * 16 + r; float x[8]; unpack8(raw[r], x); float s = 0.f;
#pragma unroll
            for (int i = 0; i < 8; ++i) { x[i] = gelu_tanh(x[i]); s += x[i]; }
            const float mean = wave_sum(s) * (1.f / 512.f); float ss = 0.f;
#pragma unroll
            for (int i = 0; i < 8; ++i) { x[i] -= mean; ss += x[i] * x[i]; }
            const float rstd = rsqrtf(wave_sum(ss) * (1.f / 512.f) + LN_EPS);
            if ((lane >> 5) == hf) { const int cl = ((lane >> 4) & 1) * 128 * 136 + 8 * (lane & 15) * 136;
#pragma unroll
                for (int i = 0; i < 8; ++i) vT[cl + i * 136 + tk] = (unsigned short)f2bf(x[i] * rstd * gn[i] + gb[i]); } } }
    __syncthreads();
#pragma unroll 1
    for (int gl = 0; gl < 2; ++gl) { const int g = 2 * hf + gl; const LAS unsigned short* vg = vT + gl * 128 * 136;
        const float* wsp = p.in[I_GMWS] + ((size_t)(l * 4 + g) * 128) * 128; const float* bsp = p.in[I_GMBS] + (l * 4 + g) * 128;
        const int c16 = lane & 15, g4 = lane >> 4, t = 16 * wave + c16, nks = ((16 * wave + 15) >> 5) + 1;
        bf16x8_t wf[4];
#pragma unroll
        for (int ks = 0; ks < 4; ++ks) { wf[ks] = (bf16x8_t){0, 0, 0, 0, 0, 0, 0, 0};
            if (ks < nks) { const float* wp = wsp + (size_t)t * 128 + 32 * ks + 8 * g4; const v4f a = *(const v4f*)wp, b = *(const v4f*)(wp + 4); const int s0 = 32 * ks + 8 * g4;
                const v4u w = (v4u){pk2(s0 <= t ? a.x : 0.f, s0 + 1 <= t ? a.y : 0.f), pk2(s0 + 2 <= t ? a.z : 0.f, s0 + 3 <= t ? a.w : 0.f), pk2(s0 + 4 <= t ? b.x : 0.f, s0 + 5 <= t ? b.y : 0.f), pk2(s0 + 6 <= t ? b.z : 0.f, s0 + 7 <= t ? b.w : 0.f)};
                wf[ks] = __builtin_bit_cast(bf16x8_t, w); } }
        pg8::f32x4 acc[8];
#pragma unroll
        for (int ct = 0; ct < 8; ++ct) acc[ct] = (pg8::f32x4){0.f, 0.f, 0.f, 0.f};
#pragma unroll
        for (int ks = 0; ks < 4; ++ks) { if (ks < nks) {
#pragma unroll
            for (int ct = 0; ct < 8; ++ct) acc[ct] = __builtin_amdgcn_mfma_f32_16x16x32_bf16(*(const LAS bf16x8_t*)(vg + (16 * ct + c16) * 136 + 32 * ks + 8 * g4), wf[ks], acc[ct], 0, 0, 0); } }
        const float bias = bsp[t]; v2u ur[8];
#pragma unroll
        for (int ct = 0; ct < 8; ++ct) ur[ct] = *(const v2u*)(Z + (tok0 + t) * ZC + ZC_GMU + g * 128 + 16 * ct + 4 * g4);
#pragma unroll
        for (int ct = 0; ct < 8; ++ct) { const float u0 = bflo(ur[ct].x), u1 = bfhi(ur[ct].x), u2 = bflo(ur[ct].y), u3 = bfhi(ur[ct].y);
            const float o0 = gelu_tanh(u0) * (acc[ct][0] + bias), o1 = gelu_tanh(u1) * (acc[ct][1] + bias), o2 = gelu_tanh(u2) * (acc[ct][2] + bias), o3 = gelu_tanh(u3) * (acc[ct][3] + bias);
#if MERGE_FP8
            *(unsigned*)((unsigned char*)(p.ws + WS_BR) + (tok0 + t) * BRW + 1 * BW + g * 128 + 16 * ct + 4 * g4) = pk4_f8(o0, o1, o2, o3, BRSC); }
#else
            *(v2u*)((bf16*)(p.ws + WS_BR) + (tok0 + t) * BRW + 1 * BW + g * 128 + 16 * ct + 4 * g4) = (v2u){pk2(o0, o1), pk2(o2, o3)}; }
#endif
    }
    __syncthreads();
}

__device__ __forceinline__ void vt_item(const Params& p, LAS unsigned char* lds, int item, int tid) {
    const int h = item & 3, n = item >> 2; const size_t t0 = (size_t)n * 64;
    const bf16* Z = (const bf16*)(p.ws + WS_Z); bf16* VT = (bf16*)(p.ws + WS_VT);
    LAS unsigned short* vs = (LAS unsigned short*)lds;
#pragma unroll
    for (int r = 0; r < 2; ++r) { const int idx = tid + 512 * r, tk = idx >> 4, c8 = idx & 15;
        *(LAS v4u*)(vs + tk * 136 + 8 * c8) = *(const v4u*)(Z + (t0 + tk) * ZC + ZC_SBV + h * 128 + 8 * c8); }
    __syncthreads();
    { const int d = tid >> 2, jq = tid & 3; unsigned w[8];
#pragma unroll
      for (int x = 0; x < 8; ++x) w[x] = (unsigned)vs[(16 * jq + 2 * x) * 136 + d] | ((unsigned)vs[(16 * jq + 2 * x + 1) * 136 + d] << 16);
      bf16* dst = VT + ((size_t)h * 128 + d) * T + t0 + 16 * jq;
      *(v4u*)dst = (v4u){w[0], w[1], w[2], w[3]}; *(v4u*)(dst + 8) = (v4u){w[4], w[5], w[6], w[7]}; }
    __syncthreads();
}
constexpr int KTP = 136, VTP = 72;
__device__ __forceinline__ void sb_unit(const Params& p, LAS unsigned char* lds, int unit, int tid, int wave, int lane) {
    const int h = unit >> 6, q0 = (unit & 63) * 128, g = lane >> 4, c = lane & 15; const int qrow = q0 + 16 * wave + c;
    const bf16* Z = (const bf16*)(p.ws + WS_Z); const bf16* VT = (const bf16*)(p.ws + WS_VT) + (size_t)h * 128 * T; bf16* BR0 = (bf16*)(p.ws + WS_BR);
    LAS unsigned short* Kt = (LAS unsigned short*)lds;
    LAS unsigned short* Vt = Kt + 2 * 64 * KTP;
    LAS int* flags = (LAS int*)(Vt + 2 * 128 * VTP);
    bf16x8_t qf[4];
#pragma unroll
    for (int ks = 0; ks < 4; ++ks) qf[ks] = *(const bf16x8_t*)(Z + (size_t)qrow * ZC + ZC_SBQ + h * 128 + 32 * ks + 8 * g);
    pg8::f32x4 acc[8];
#pragma unroll
    for (int dt = 0; dt < 8; ++dt) acc[dt] = (pg8::f32x4){0.f, 0.f, 0.f, 0.f};
    float racc = 0.f;
    v4u kr[2], vr[2];
    const int jt = (q0 >> 6) + 1;
#define SB_GLOAD(j_) do { _Pragma("unroll") for (int r = 0; r < 2; ++r) { const int idx = tid + 512 * r; \
        kr[r] = *(const v4u*)(Z + (size_t)(64 * (j_) + (idx >> 4)) * ZC + ZC_SBK + h * 128 + 8 * (idx & 15)); \
        vr[r] = *(const v4u*)(VT + (size_t)(idx >> 3) * T + 64 * (j_) + 8 * (idx & 7)); } } while (0)
#define SB_LWRITE(b_) do { _Pragma("unroll") for (int r = 0; r < 2; ++r) { const int idx = tid + 512 * r; \
        *(LAS v4u*)(Kt + (b_) * 64 * KTP + (idx >> 4) * KTP + 8 * (idx & 15)) = kr[r]; *(LAS v4u*)(Vt + (b_) * 128 * VTP + (idx >> 3) * VTP + 8 * (idx & 7)) = vr[r]; } } while (0)
    LDS_BAR();
    SB_GLOAD(jt); SB_LWRITE(0);
    LDS_BAR();
    for (int j = jt, it = 0; j >= 0; --j, ++it) {
        const int cur = it & 1;
        SB_GLOAD(j > 0 ? j - 1 : 0);
        const bool wdone = __all(racc > 104.f);
        if (64 * j < q0 + 16 * wave + 15 && !wdone) {
            const LAS unsigned short* Kc = Kt + cur * 64 * KTP; const LAS unsigned short* Vc = Vt + cur * 128 * VTP;
            pg8::f32x4 z[4];
#pragma unroll
            for (int s = 0; s < 4; ++s) { z[s] = (pg8::f32x4){0.f, 0.f, 0.f, 0.f};
#pragma unroll
                for (int ks = 0; ks < 4; ++ks) z[s] = __builtin_amdgcn_mfma_f32_16x16x32_bf16(*(const LAS bf16x8_t*)(Kc + (16 * s + c) * KTP + 32 * ks + 8 * g), qf[ks], z[s], 0, 0, 0); }
            float sp[4][4], t[4], xs[4]; bool mk[4][4];
#pragma unroll
            for (int s = 0; s < 4; ++s) { t[s] = 0.f;
#pragma unroll
                for (int r = 0; r < 4; ++r) { const int key = 64 * j + 16 * s + 4 * g + r; mk[s][r] = key < qrow; const float zz = z[s][r] * 0.08838834764831845f; z[s][r] = zz;
                    sp[s][r] = mk[s][r] ? softplusf_(zz) : 0.f; t[s] += sp[s][r]; } }
            float grand = 0.f, higher[4];
#pragma unroll
            for (int s = 3; s >= 0; --s) { float x = t[s]; float y = __shfl(x, lane + 16); x += (g < 3) ? y : 0.f; y = __shfl(x, lane + 32); x += (g < 2) ? y : 0.f;
                xs[s] = x - t[s];
                const float tot = __shfl(x, c); higher[s] = grand; grand += tot; }
            bf16x8_t pf[2];
#pragma unroll
            for (int s = 0; s < 4; ++s) { float a[4]; float e = 0.f;
#pragma unroll
                for (int r = 3; r >= 0; --r) { const float la = z[s][r] - sp[s][r] - (racc + higher[s] + xs[s] + e); a[r] = mk[s][r] ? __expf(la) : 0.f; e += sp[s][r]; }
                const unsigned w0 = pk2(a[0], a[1]), w1 = pk2(a[2], a[3]);
                if ((s & 1) == 0) { pf[s >> 1][0] = (short)(w0 & 0xffff); pf[s >> 1][1] = (short)(w0 >> 16); pf[s >> 1][2] = (short)(w1 & 0xffff); pf[s >> 1][3] = (short)(w1 >> 16); }
                else              { pf[s >> 1][4] = (short)(w0 & 0xffff); pf[s >> 1][5] = (short)(w0 >> 16); pf[s >> 1][6] = (short)(w1 & 0xffff); pf[s >> 1][7] = (short)(w1 >> 16); } }
            racc += grand;
#pragma unroll
            for (int dt = 0; dt < 8; ++dt)
#pragma unroll
                for (int k2 = 0; k2 < 2; ++k2) { const v2u lo = *(const LAS v2u*)(Vc + (16 * dt + c) * VTP + 32 * k2 + 4 * g), hi = *(const LAS v2u*)(Vc + (16 * dt + c) * VTP + 32 * k2 + 16 + 4 * g);
                    const v4u vv = (v4u){lo.x, lo.y, hi.x, hi.y};
                    acc[dt] = __builtin_amdgcn_mfma_f32_16x16x32_bf16(__builtin_bit_cast(bf16x8_t, vv), pf[k2], acc[dt], 0, 0, 0); }
        }
        const bool wd2 = __all(racc > 104.f);
        if (lane == 0) flags[cur * 8 + wave] = wd2 ? 1 : 0;
        SB_LWRITE(cur ^ 1);
        LDS_BAR();
        int alld = 1;
#pragma unroll
        for (int w = 0; w < 8; ++w) alld &= flags[cur * 8 + w];
        if (alld) break;
    }
#undef SB_GLOAD
#undef SB_LWRITE
#pragma unroll
#if MERGE_FP8
    for (int dt = 0; dt < 8; ++dt) *(unsigned*)((unsigned char*)BR0 + (size_t)qrow * BRW + h * 128 + 16 * dt + 4 * g) = pk4_f8(acc[dt][0], acc[dt][1], acc[dt][2], acc[dt][3], BRSC);
#else
    for (int dt = 0; dt < 8; ++dt) { v2u w; w.x = pk2(acc[dt][0], acc[dt][1]); w.y = pk2(acc[dt][2], acc[dt][3]); *(v2u*)(BR0 + (size_t)qrow * BRW + h * 128 + 16 * dt + 4 * g) = w; }
#endif
}

struct GateOrder {
    pg8::StaticOrder s; int pn0;
    __device__ __forceinline__ bool next(int i, pg8::Unit& u) const { if (!s.next(i, u)) return false; u.pn += pn0; return true; }
    __device__ __forceinline__ void a_ready(const pg8::Unit&) const {}
    __device__ __forceinline__ void done(const pg8::Unit&) const {}
};
constexpr int GATE_PN0 = ZC_GATE / 256, GATE_WGS = 128;
__device__ __forceinline__ void phase_mixers(const Params& p, int l, LAS unsigned char* lds, int wg, int G, int tid, int wave, int lane, const XcdBarrier& bar) {
#if defined(PROBE_SPLIT)
    if (wg < 16) gdn_seq2(p, lds, wg, tid, wave, lane); else if (wg < 36) ml_seq2(p, lds, wg - 16, tid, wave, lane);
    xcd_barrier(bar);
    const int w2 = wg, G2 = G;
#else
    if (wg < 16) { gdn_seq2(p, lds, wg, tid, wave, lane); return; }
    if (wg < 36) { ml_seq2(p, lds, wg - 16, tid, wave, lane); return; }
    const int w2 = wg - 36, G2 = G - 36;
#endif
    if (GATE_SPLIT && G == 256) {
        if (w2 < GATE_WGS) {
            for (int it = w2; it < 128; it += GATE_WGS) mixer_gmlp_item(p, l, lds, it, tid, wave, lane);
            for (int it = w2; it < 256; it += GATE_WGS) sb_unit(p, lds, it, tid, wave, lane);
            __syncthreads();
            pg8::Gemm g{(const bf16*)(p.ws + WS_XB), (const bf16*)(p.ws + WS_WIN), T, ZC, D / 2, D / 2, D / 2}; GateOrder S; S.s.init(T, ZC - ZC_GATE, GATE_WGS, w2); S.pn0 = GATE_PN0;
#if GATE_FP8
            EpiGate8 E{p.ws + WS_MTMP, 1.f / 64.f};
            pg8::gemm_phase<EpiGate8, GateOrder, true, true, true>(lds, g, S, E);
#else
            pg8::EpiBf16<0> E{(bf16*)(p.ws + WS_Z), ZC, nullptr, 0, 0, 1.f / 64.f};
            pg8::gemm_phase<pg8::EpiBf16<0>, GateOrder, true, true, true>(lds, g, S, E);
#endif
        } else { const int w3 = w2 - GATE_WGS, G3 = G2 - GATE_WGS; __syncthreads();
            phase_convert<1>(p, l, lds, w3 * 8 + wave, G3 * 8, wave, lane); }
        return; }
    for (int it = w2; it < 128; it += G2) mixer_gmlp_item(p, l, lds, it, tid, wave, lane);
    for (int it = w2; it < 256; it += G2) sb_unit(p, lds, it, tid, wave, lane);
#if !defined(PROBE_CONV0)
    __syncthreads();
    {
        constexpr int NIT1 = (NEX * 2 * (D / 64) * (ED / 32)) + (NEX * (ED / 64) * (D / 32));
        const int nheavy = (G2 < 256 && 2 * G2 >= 256) ? 256 - G2 : 0, per_wave = NIT1 / (G2 * 8);
        const int NA = (nheavy > 0 && per_wave > 2 * CONV_SKIP) ? (per_wave - CONV_SKIP) * (G2 * 8) : NIT1;
        phase_convert<1>(p, l, lds, w2 * 8 + wave, G2 * 8, wave, lane, false, 0, NA);
        if (NA < NIT1 && w2 >= nheavy) phase_convert<1>(p, l, lds, (w2 - nheavy) * 8 + wave, (G2 - nheavy) * 8, wave, lane, false, NA, NIT1); }
#endif
}

__device__ __forceinline__ void phase_post(const Params& p, int l, int gw, int NGW, int lane) {
    const bf16* Z = (const bf16*)(p.ws + WS_Z); const float* GO = (const float*)(p.ws + WS_GO); const float* HO = (const float*)(p.ws + WS_HO); const float* HDEN = (const float*)(p.ws + WS_HDEN);
    bf16* BR2 = (bf16*)(p.ws + WS_BR) + 2 * BW; bf16* BR3 = (bf16*)(p.ws + WS_BR) + 3 * BW;
    const float* gng = p.in[I_GDNNG] + l * 128; const float* mng = p.in[I_MLNG] + l * BW;
    for (int t = gw; t < T; t += NGW) {
        {   const v4f a0 = *(const v4f*)(GO + (size_t)t * BW + 8 * lane), a1 = *(const v4f*)(GO + (size_t)t * BW + 8 * lane + 4); float o[8] = {a0.x, a0.y, a0.z, a0.w, a1.x, a1.y, a1.z, a1.w}; float ss = 0.f;
#pragma unroll
            for (int i = 0; i < 8; ++i) ss += o[i] * o[i];
            const float r = rsqrtf(sum16(ss) * (1.f / 128.f) + LN_EPS);
            const v4u graw = *(const v4u*)(Z + (size_t)t * ZC + ZC_GDNG + 8 * lane); float gt[8]; unpack8(graw, gt);
#pragma unroll
            for (int i = 0; i < 8; ++i) o[i] = o[i] * r * gng[(8 * lane + i) & 127] * siluf_(gt[i]);
#if MERGE_FP8
            *(v2u*)((unsigned char*)(p.ws + WS_BR) + (size_t)t * BRW + 2 * BW + 8 * lane) = (v2u){pk4_f8(o[0], o[1], o[2], o[3], BRSC), pk4_f8(o[4], o[5], o[6], o[7], BRSC)}; }
#else
            v4u w; w.x = pk2(o[0], o[1]); w.y = pk2(o[2], o[3]); w.z = pk2(o[4], o[5]); w.w = pk2(o[6], o[7]); *(v4u*)(BR2 + (size_t)t * BRW + 8 * lane) = w; }
#endif
        {   const v4f a0 = *(const v4f*)(HO + (size_t)t * BW + 8 * lane), a1 = *(const v4f*)(HO + (size_t)t * BW + 8 * lane + 4); float o[8] = {a0.x, a0.y, a0.z, a0.w, a1.x, a1.y, a1.z, a1.w}; float ss = 0.f;
            const float dn = __builtin_amdgcn_rcpf(fmaxf(fabsf(HDEN[(size_t)t * 4 + (lane >> 4)]), 1.f));
#pragma unroll
            for (int i = 0; i < 8; ++i) { o[i] *= dn; ss += o[i] * o[i]; }
            const float r = rsqrtf(sum16(ss) * (1.f / 128.f) + LN_EPS);
            const v4u graw = *(const v4u*)(Z + (size_t)t * ZC + ZC_MLO + 8 * lane); float gt[8]; unpack8(graw, gt);
#pragma unroll
            for (int i = 0; i < 8; ++i) o[i] = o[i] * r * mng[8 * lane + i] * sigmoidf_(gt[i]);
#if MERGE_FP8
            *(v2u*)((unsigned char*)(p.ws + WS_BR) + (size_t)t * BRW + 3 * BW + 8 * lane) = (v2u){pk4_f8(o[0], o[1], o[2], o[3], BRSC), pk4_f8(o[4], o[5], o[6], o[7], BRSC)}; }
#else
            v4u w; w.x = pk2(o[0], o[1]); w.y = pk2(o[2], o[3]); w.z = pk2(o[4], o[5]); w.w = pk2(o[6], o[7]); *(v4u*)(BR3 + (size_t)t * BRW + 8 * lane) = w; }
#endif
    }
}

__device__ __forceinline__ void ln_row(const float* yrow, const float* g, const float* b, int lane, v4f (&v)[8]) {
    const v4f* yr = (const v4f*)yrow + lane; float s = 0.f;
#pragma unroll
    for (int j = 0; j < 8; ++j) { v[j] = yr[64 * j]; s += (v[j].x + v[j].y) + (v[j].z + v[j].w); }
    const float mean = wave_sum(s) * (1.f / D); float s2 = 0.f;
#pragma unroll
    for (int j = 0; j < 8; ++j) { v[j] = v[j] - mean; s2 += (v[j].x * v[j].x + v[j].y * v[j].y) + (v[j].z * v[j].z + v[j].w * v[j].w); }
    const float rstd = rsqrtf(wave_sum(s2) * (1.f / D) + LN_EPS);
#pragma unroll
    for (int j = 0; j < 8; ++j) { const v4f gg = ((const v4f*)g)[lane + 64 * j], bb = ((const v4f*)b)[lane + 64 * j]; v[j] = v[j] * rstd * gg + bb; }
}
constexpr int RT_XP = 2052;
constexpr int RT_TAB = 131072 + 1024;
__device__ __forceinline__ void phase_ln1_router(const Params& p, int l, LAS unsigned char* lds, int wg, int G, int wave, int lane, int cnt_shift = 0) {
    const bf16* Y = (const bf16*)(p.ws + WS_Y); bf16* X1 = (bf16*)(p.ws + WS_X1); bf16* X1B = (bf16*)(p.ws + WS_X1B); int* LIST = (int*)(p.ws + WS_LIST); float* WL = (float*)(p.ws + WS_WL); unsigned* SLOT = (unsigned*)(p.ws + WS_SLOT);
    unsigned* cnt = (unsigned*)(p.ws + WS_CTL) + CW_CNT + l * 4096 + cnt_shift;
    const float* g1 = p.in[I_LN1G] + (size_t)l * D; const float* b1 = p.in[I_LN1B] + (size_t)l * D;
    const float* wr = p.in[I_WR] + (size_t)l * D * NE; const float rbias = p.in[I_RB][l * NE + lane];
    LAS float* xt = (LAS float*)lds;
    LAS float* part = (LAS float*)lds;
    LAS unsigned char* selm = lds + RT_TAB; LAS unsigned char* rkm = selm + 4096; LAS float* wtm = (LAS float*)(rkm + 4096); LAS unsigned* basem = (LAS unsigned*)(wtm + 4096);
    const int n_l = lane & 15, kq = lane >> 4;
    int gi = 0;
    for (int tg = wg; tg < T / 16; tg += G, ++gi) {
        {   v4f va[8], vb[8]; const size_t m0 = (size_t)tg * 16 + 2 * wave;
#pragma unroll
            for (int j = 0; j < 8; ++j) { va[j] = ld4(Y, m0 * D + 4 * lane + 256 * j, true); vb[j] = ld4(Y, (m0 + 1) * D + 4 * lane + 256 * j, true); }
            float sa = 0.f, sb = 0.f;
#pragma unroll
            for (int j = 0; j < 8; ++j) { sa += (va[j].x + va[j].y) + (va[j].z + va[j].w); sb += (vb[j].x + vb[j].y) + (vb[j].z + vb[j].w); }
            const float ma = wave_sum(sa) * (1.f / D), mb = wave_sum(sb) * (1.f / D); float qa = 0.f, qb = 0.f;
#pragma unroll
            for (int j = 0; j < 8; ++j) { va[j] = va[j] - ma; vb[j] = vb[j] - mb; qa += (va[j].x * va[j].x + va[j].y * va[j].y) + (va[j].z * va[j].z + va[j].w * va[j].w); qb += (vb[j].x * vb[j].x + vb[j].y * vb[j].y) + (vb[j].z * vb[j].z + vb[j].w * vb[j].w); }
            const float ra = rsqrtf(wave_sum(qa) * (1.f / D) + LN_EPS), rb = rsqrtf(wave_sum(qb) * (1.f / D) + LN_EPS);
#pragma unroll
            for (int j = 0; j < 8; ++j) { const v4f gg = ((const v4f*)g1)[lane + 64 * j], bb = ((const v4f*)b1)[lane + 64 * j]; va[j] = va[j] * ra * gg + bb; vb[j] = vb[j] * rb * gg + bb; }
#pragma unroll
            for (int rr = 0; rr < 2; ++rr) { const size_t m = m0 + rr; v2u* xo = (v2u*)(X1 + m * D) + lane;
#pragma unroll
                for (int j = 0; j < 8; ++j) { const v4f v = rr ? vb[j] : va[j]; xo[64 * j] = (v2u){pk2(v.x, v.y), pk2(v.z, v.w)};
#if MOE_UP_FP8
                    { unsigned w = 0; w = __builtin_amdgcn_cvt_pk_fp8_f32(v.x, v.y, w, false); w = __builtin_amdgcn_cvt_pk_fp8_f32(v.z, v.w, w, true); ((unsigned*)((unsigned char*)X1B + m * D))[lane + 64 * j] = w; }
#else
                    { v2u o; o.x = pk2(v.x, v.y); o.y = pk2(v.z, v.w); ((v2u*)(X1B + m * D))[lane + 64 * j] = o; }
#endif
                    *(LAS v4f*)(xt + (2 * wave + rr) * RT_XP + 4 * lane + 256 * j) = v; } } }
        __syncthreads();
        {   pg8::f32x4 acc[4];
#pragma unroll
            for (int i = 0; i < 4; ++i) acc[i] = (pg8::f32x4){0.f, 0.f, 0.f, 0.f};
            const float* wb = wr + (size_t)(256 * wave + 4 * kq) * NE + 4 * n_l;
            const LAS float* xa = xt + n_l * RT_XP + 256 * wave + 4 * kq;
            v4f bwa[16], bwb[16];
#define RT_LOADW(dst, sb_) do { _Pragma("unroll") for (int q = 0; q < 16; ++q) dst[q] = *(const v4f*)(wb + (size_t)(16 * (4 * (sb_) + (q >> 2)) + (q & 3)) * NE); } while (0)
#define RT_MMA(src, sb_) do { _Pragma("unroll") for (int sg = 0; sg < 4; ++sg) { const v4f a4 = *(const LAS v4f*)(xa + 16 * (4 * (sb_) + sg)); \
                _Pragma("unroll") for (int c = 0; c < 4; ++c) { const v4f b4 = src[sg * 4 + c]; const float a = c == 0 ? a4.x : c == 1 ? a4.y : c == 2 ? a4.z : a4.w; \
                    acc[0] = __builtin_amdgcn_mfma_f32_16x16x4f32(a, b4.x, acc[0], 0, 0, 0); acc[1] = __builtin_amdgcn_mfma_f32_16x16x4f32(a, b4.y, acc[1], 0, 0, 0); \
                    acc[2] = __builtin_amdgcn_mfma_f32_16x16x4f32(a, b4.z, acc[2], 0, 0, 0); acc[3] = __builtin_amdgcn_mfma_f32_16x16x4f32(a, b4.w, acc[3], 0, 0, 0); } } } while (0)
            RT_LOADW(bwa, 0);
#pragma unroll 1
            for (int h = 0; h < 2; ++h) {
                RT_LOADW(bwb, 1); RT_MMA(bwa, 0);
                if (h == 0) RT_LOADW(bwa, 2);
                RT_MMA(bwb, 1);
                wb += (size_t)128 * NE; xa += 128; asm volatile("" : "+v"(wb));
            }
#undef RT_LOADW
#undef RT_MMA
            __syncthreads();
#pragma unroll
            for (int j = 0; j < 4; ++j) *(LAS v4f*)(part + (wave * 16 + 4 * kq + j) * 64 + 4 * n_l) = (v4f){acc[0][j], acc[1][j], acc[2][j], acc[3][j]}; }
        __syncthreads();
#pragma unroll 1
        for (int rr = 0; rr < 2; ++rr) { const int lr = wave + 8 * rr; float logit = 0.f;
#pragma unroll
            for (int w = 0; w < 8; ++w) logit += part[(w * 16 + lr) * 64 + lane];
            const float s = sigmoid_div(logit), biased = s + rbias;
            const float m1 = max8(biased); const float li = (float)(lane & 7);
            const float first = min8(biased == m1 ? li : 8.f);
            const float m2 = max8(li == first ? -INFINITY : biased);
            const float gs = m1 + m2; const int myg = lane >> 3; int grank = 0;
#pragma unroll
            for (int g2 = 0; g2 < 8; ++g2) { const float o = __builtin_bit_cast(float, __builtin_amdgcn_readlane(__builtin_bit_cast(int, gs), g2 * 8)); grank += (o > gs || (o == gs && g2 < myg)) ? 1 : 0; }
            const float masked = grank < 4 ? biased : -INFINITY; int rank = 0;
#pragma unroll 8
            for (int e2 = 0; e2 < 64; ++e2) { const float o = __builtin_bit_cast(float, __builtin_amdgcn_readlane(__builtin_bit_cast(int, masked), e2)); rank += (o > masked || (o == masked && e2 < lane)) ? 1 : 0; }
            const float wsel = rank < 6 ? s : 0.f; const float tot = wave_sum(wsel);
            const int ri = gi * 16 + lr;
            selm[ri * 64 + lane] = (rank < 6) ? 1 : 0; rkm[ri * 64 + lane] = (unsigned char)rank; wtm[ri * 64 + lane] = wsel / tot * 2.5f; }
        __syncthreads();
    }
    const int nrows = gi * 16;
    if (wave == 0) { unsigned n = 0;
        for (int r = 0; r < nrows; ++r) n += selm[r * 64 + lane];
        unsigned base = 0; if (n && !(PROBE_NOATOM && cnt_shift)) base = __hip_atomic_fetch_add(cnt + 64 * lane, n, __ATOMIC_RELAXED, __HIP_MEMORY_SCOPE_AGENT);
        basem[lane] = base; }
    __syncthreads();
    for (int ri = wave; ri < nrows; ri += 8) { unsigned pos = basem[lane];
        for (int r = 0; r < ri; ++r) pos += selm[r * 64 + lane];
        if (selm[ri * 64 + lane]) { const size_t m = (size_t)(wg + (ri >> 4) * G) * 16 + (ri & 15); const int rk = rkm[ri * 64 + lane];
            LIST[lane * T + pos] = (int)m; WL[lane * T + pos] = wtm[ri * 64 + lane]; SLOT[m * 8 + rk] = ((unsigned)lane << 16) | pos; } }
    __syncthreads();
}
__device__ __forceinline__ void phase_combine_ln2(const Params& p, int l, void* dst, bool dbf, int gw, int NGW, int lane) {
    const bf16* X1 = (const bf16*)(p.ws + WS_X1); const bf16* YE = (const bf16*)(p.ws + WS_YEXP); const unsigned* SLOT = (const unsigned*)(p.ws + WS_SLOT);
    const unsigned* cnt = (const unsigned*)(p.ws + WS_CTL) + CW_CNT + l * 4096;
    const float* g2 = p.in[I_LN2G] + (size_t)l * D; const float* b2 = p.in[I_LN2B] + (size_t)l * D;
    const int tiles = ((int)cnt[64 * lane] + 255) >> 8; const float incl = wave_scan_incl((float)tiles);
    const int toff = (int)incl - tiles;
    const int tsh = __builtin_amdgcn_readlane((int)incl, 63);
    for (int m = gw; m < T; m += NGW) {
        v4f v[8];
#pragma unroll
        for (int j = 0; j < 8; ++j) v[j] = ld4(X1, (size_t)m * D + 4 * lane + 256 * j, true) * ALPHA;
#pragma unroll
        for (int k = 0; k < 7; ++k) { size_t row;
            if (k == 0) row = (size_t)tsh * 256 + m;
            else { const unsigned s = __builtin_amdgcn_readfirstlane(SLOT[(size_t)m * 8 + (k - 1)]); const int e = (int)(s >> 16); row = (size_t)__builtin_amdgcn_readlane(toff, e) * 256 + (s & 0xffffu); }
#if YEXP_FP8
            const unsigned* yr = (const unsigned*)((const unsigned char*)YE + row * D) + lane;
#pragma unroll
            for (int j = 0; j < 8; ++j) { const unsigned y = yr[64 * j]; const auto lo = __builtin_amdgcn_cvt_pk_f32_fp8(y, false), hi = __builtin_amdgcn_cvt_pk_f32_fp8(y, true);
                v[j].x += lo[0] * (1.f / YSC); v[j].y += lo[1] * (1.f / YSC); v[j].z += hi[0] * (1.f / YSC); v[j].w += hi[1] * (1.f / YSC); } }
#else
            const v2u* yr = (const v2u*)(YE + row * D) + lane;
#pragma unroll
            for (int j = 0; j < 8; ++j) { const v2u y = yr[64 * j]; v[j].x += bflo(y.x); v[j].y += bfhi(y.x); v[j].z += bflo(y.y); v[j].w += bfhi(y.y); } }
#endif
        float s = 0.f;
#pragma unroll
        for (int j = 0; j < 8; ++j) s += (v[j].x + v[j].y) + (v[j].z + v[j].w);
        const float mean = wave_sum(s) * (1.f / D); float s2 = 0.f;
#pragma unroll
        for (int j = 0; j < 8; ++j) { v[j] = v[j] - mean; s2 += (v[j].x * v[j].x + v[j].y * v[j].y) + (v[j].z * v[j].z + v[j].w * v[j].w); }
        const float rstd = rsqrtf(wave_sum(s2) * (1.f / D) + LN_EPS);
#pragma unroll
        for (int j = 0; j < 8; ++j) { const v4f gg = ((const v4f*)g2)[lane + 64 * j], bb = ((const v4f*)b2)[lane + 64 * j]; const v4f o = v[j] * rstd * gg + bb;
            if (dbf) ((v2u*)((bf16*)dst + (size_t)m * D))[lane + 64 * j] = (v2u){pk2(o.x, o.y), pk2(o.z, o.w)};
            else ((v4f*)((float*)dst + (size_t)m * D))[lane + 64 * j] = o; }
    }
}

constexpr int NPH = 11;
template <class S> struct DupOrder {
    S s; int n;
    __device__ __forceinline__ bool next(int i, Unit& u) const { return s.next(i >= n ? i - n : i, u); }
    __device__ __forceinline__ int row_token(int i, int r) const { return s.row_token(i >= n ? i - n : i, r); }
    __device__ __forceinline__ void a_ready(const Unit& u) const { s.a_ready(u); }
    __device__ __forceinline__ void done(const Unit& u) const { s.done(u); }
};
template <class S> __device__ __forceinline__ int count_units(const S& s) { Unit u; int n = 0; while (n < 64 && s.next(n, u)) ++n; return n; }
#define ORDER_T(k, T) typename std::conditional<PROBE_DUP == (k), DupOrder<T>, T>::type
template <class S> __device__ __forceinline__ DupOrder<S> make_order(const S& s, std::true_type) { DupOrder<S> d{s, count_units(s)}; d.n = count_units(s); return d; }
template <class S> __device__ __forceinline__ S make_order(const S& s, std::false_type) { return s; }
#define MAKE_ORDER(k, s) make_order(s, std::integral_constant<bool, PROBE_DUP == (k)>())
template <int l>
__device__ __forceinline__ void run_layer(const Params& p, LAS unsigned char* lds, const XcdBarrier& bar, int tid, int lane, int wave, int G, int wg, int gw, int NGW) {
    unsigned char* ws = p.ws;
    {
        const void* xin = (l == 0) ? (const void*)p.in[I_X] : (const void*)(ws + WS_XCUR);
        void* xout = (l == NL - 1) ? (void*)p.out : (void*)(ws + WS_XCUR);
#ifndef PROBE_DUP
#define PROBE_DUP (-1)
#endif
#define IS_GEMM_PH(k) ((k) == 1 || (k) == 5 || (k) == 6 || (k) == 8 || (k) == 9)
#define REP(k) _Pragma("nounroll") for (int _r = 0; _r < ((PROBE_DUP == (k) && !IS_GEMM_PH(k)) ? 2 + (p.ph_lo >> 20) : 1); ++_r)
#ifndef PH_MASK
#define PH_MASK 0x7ff
#endif
#define RUN(k) (((PH_MASK >> (k)) & 1) && p.ph_lo <= l * NPH + (k) && l * NPH + (k) < p.ph_hi)
#define SEAM(k) do { if (l * NPH + (k) + 1 < p.ph_hi) xcd_barrier(bar); } while (0)
        if (RUN(0)) { REP(0) { phase_convert<0>(p, l, lds, gw, NGW, wave, lane);
#if defined(PROBE_CONV0)
            phase_convert<1>(p, l, lds, gw, NGW, wave, lane);
#endif
 phase_xprep(p, l, xin, l > 0, lds, gw, NGW, tid, lane); } SEAM(0); }
        if (RUN(1)) { REP(1) { pg8::Gemm g{(const bf16*)(ws + WS_XB), (const bf16*)(ws + WS_WIN), T, ZC, D / 2, D / 2, D / 2}; pg8::StaticOrder S; S.init(T, (GATE_SPLIT && G == 256) ? ZC_GATE : ZC, G, wg);
            pg8::EpiBf16<0> E{(bf16*)(ws + WS_Z), ZC, nullptr, 0, 0, 1.f / 64.f};
            auto S2 = MAKE_ORDER(1, S); pg8::gemm_phase<pg8::EpiBf16<0>, ORDER_T(1, pg8::StaticOrder), true, true, true>(lds, g, S2, E); } SEAM(1); }
        if (RUN(2)) { REP(2) { for (int it = wg; it < 1536; it += G) { if (it < 512) gdn_pre_item(p, l, lds, it, tid, wave, lane); else if (it < 1024) ml_pre_item(p, l, lds, it - 512, tid, wave, lane); else vt_item(p, lds, it - 1024, tid); } } SEAM(2); }
        if (RUN(3)) { REP(3) { phase_mixers(p, l, lds, wg, G, tid, wave, lane, bar); } SEAM(3); }
        if (RUN(4)) { REP(4) { phase_post(p, l, gw, NGW, lane); } SEAM(4); }
        if (RUN(5)) { REP(5) { constexpr int KM = MERGE_FP8 ? BRW / 2 : BRW; pg8::Gemm g{(const bf16*)(ws + WS_BR), (const bf16*)(ws + WS_WBR), T, D, KM, KM, KM}; pg8::StaticOrder S; S.init(T, D, G, wg);
            EpiMergeH E{(const bf16*)(ws + ((GATE_FP8 && GATE_SPLIT && G == 256) ? WS_MTMP : WS_Z)), (bf16*)(ws + WS_MSUM)};
            auto S2 = MAKE_ORDER(5, S); pg8::gemm_phase<EpiMergeH, ORDER_T(5, pg8::StaticOrder), true, true, MERGE_FP8 != 0>(lds, g, S2, E); } SEAM(5); }
        if (RUN(6)) { REP(6) { pg8::Gemm g{(const bf16*)(ws + WS_MSUM), (const bf16*)(ws + WS_WOUT), T, D, D / 2, D / 2, D / 2}; pg8::StaticOrder S; S.init(T, D, G, wg);
            EpiResid E{xin, (bf16*)(ws + WS_Y), 1.f / 64.f, l > 0};
            auto S2 = MAKE_ORDER(6, S); pg8::gemm_phase<EpiResid, ORDER_T(6, pg8::StaticOrder), true, true, true>(lds, g, S2, E); } SEAM(6); }
        if (RUN(7)) { REP(7) { phase_ln1_router(p, l, lds, wg, G, wave, lane, (PROBE_DUP == 7 && _r == 0) ? 16384 : 0); } SEAM(7); }
        if (RUN(8)) { REP(8) { const unsigned* cnt = (const unsigned*)(ws + WS_CTL) + CW_CNT + l * 4096; MoeTab M(lds); moe_tables(M, cnt, tid, lane, wave);
            UpOrder S{M, 0}; S.n = up_order_build(M, (const int*)(ws + WS_LIST), (const float*)(ws + WS_WL), wg, G, tid);
            constexpr int KU = MOE_UP_FP8 ? D / 2 : D;
            pg8::Gemm g{(const bf16*)(ws + WS_X1B), (const bf16*)(ws + WS_WUP), T, NEX * 1024, KU, KU, KU};
            EpiGluSparse E{(LAS const float*)M.wt, (bf16*)(ws + WS_HB)};
            auto S2 = MAKE_ORDER(8, S); pg8::gemm_phase_gather<EpiGluSparse, ORDER_T(8, UpOrder), MOE_UP_FP8 != 0>(lds, g, S2, E); } SEAM(8); }
        if (RUN(9)) { REP(9) { const unsigned* cnt = (const unsigned*)(ws + WS_CTL) + CW_CNT + l * 4096; MoeTab M(lds); moe_tables(M, cnt, tid, lane, wave);
            DownOrder S{M, G, wg, 8 * M.t[65]};
            constexpr int KD = MOE_DN_FP8 ? ED / 2 : ED;
            pg8::Gemm g{(const bf16*)(ws + WS_HB), (const bf16*)(ws + WS_WDN), HROWS, NEX * D, KD, KD, KD};
            EpiYexp E{(bf16*)(ws + WS_YEXP)};
            auto S2 = MAKE_ORDER(9, S); pg8::gemm_phase<EpiYexp, ORDER_T(9, DownOrder), true, true, MOE_DN_FP8 != 0>(lds, g, S2, E); } SEAM(9); }
        if (RUN(10)) { REP(10) { phase_combine_ln2(p, l, xout, l != NL - 1, gw, NGW, lane); } SEAM(10); }
#undef RUN
#undef SEAM
    }
}
__global__ void __launch_bounds__(512, 2) fwd_kernel(Params p) {
    extern __shared__ __attribute__((aligned(16))) unsigned char lds_raw[];
    LAS unsigned char* lds = (LAS unsigned char*)lds_raw;
    const int tid = threadIdx.x, lane = tid & 63, wave = __builtin_amdgcn_readfirstlane(tid >> 6);
    const int G = gridDim.x, wg = blockIdx.x, gw = wg * 8 + wave, NGW = G * 8;
    volatile LAS unsigned* MISC = (volatile LAS unsigned*)(lds + MISC_OFF);
    if (tid < 32) MISC[tid] = 0u;
    __syncthreads();
    unsigned* ctl = (unsigned*)(p.ws + WS_CTL);
    const bool multi = (p.ph_hi - p.ph_lo) > 1;
    XcdBarrier bar; bar.bar = ctl + CW_BAR; bar.x = 0; bar.st = nullptr;
    if (multi) bar = xcd_barrier_post(ctl + CW_BAR, MISC + 8);
    run_layer<0>(p, lds, bar, tid, lane, wave, G, wg, gw, NGW);
    run_layer<1>(p, lds, bar, tid, lane, wave, G, wg, gw, NGW);
}

#ifndef MK_MULTI_LAUNCH
#define MK_MULTI_LAUNCH 0
#endif
extern "C" void kernel_launch(void* const* d_in, const int* in_sizes, int n_in, void* d_out, int out_size, void* d_ws, size_t ws_size, hipStream_t stream) {
    static int grid = 0;
    if (grid == 0) {
        if (n_in != 27 || out_size != T * D || ws_size < WS_END) { fprintf(stderr, "kernel_launch: unexpected shapes (n_in %d out %d ws %zu need %zu)\n", n_in, out_size, ws_size, (size_t)WS_END); grid = -1; return; }
        int dev = 0, cus = 0, per_cu = 0;
        if (hipGetDevice(&dev) != hipSuccess || hipDeviceGetAttribute(&cus, hipDeviceAttributeMultiprocessorCount, dev) != hipSuccess) { grid = -1; return; }
        if (hipFuncSetAttribute((const void*)fwd_kernel, hipFuncAttributeMaxDynamicSharedMemorySize, LDS_BYTES) != hipSuccess) { fprintf(stderr, "kernel_launch: hipFuncSetAttribute failed\n"); grid = -1; return; }
        if (hipOccupancyMaxActiveBlocksPerMultiprocessor(&per_cu, (const void*)fwd_kernel, 512, LDS_BYTES) != hipSuccess || per_cu < 1) { fprintf(stderr, "kernel_launch: occupancy query says %d\n", per_cu); }
        (void)hipGetLastError();
        grid = cus;
        if (GATE_FP8 && GATE_SPLIT && cus != 256) { fprintf(stderr, "kernel_launch: this build's phase-3 role split assumes 256 CUs (have %d)\n", cus); grid = -1; return; }
    }
    if (grid < 0) return;
    (void)hipMemsetAsync((char*)d_ws + WS_CTL, 0, CTL_ZERO_BYTES, stream);
    Params p{};
    for (int i = 0; i < 27; ++i) p.in[i] = (const float*)d_in[i];
    p.out = (float*)d_out; p.ws = (unsigned char*)d_ws;
#if MK_MULTI_LAUNCH
    for (int ph = 0; ph < NL * NPH; ++ph) { p.ph_lo = ph; p.ph_hi = ph + 1; hipLaunchKernelGGL(fwd_kernel, dim3(grid), dim3(512), LDS_BYTES, stream, p); }
#else
    p.ph_lo = 0; p.ph_hi = NL * NPH; hipLaunchKernelGGL(fwd_kernel, dim3(grid), dim3(512), LDS_BYTES, stream, p);
#endif
}
```

```cpp
#include <hip/hip_runtime.h>
#include <cstdio>
#include <cstdint>
#include <type_traits>
namespace pg8 {
#define PG8_LAS __attribute__((address_space(3)))
typedef unsigned short bf16_t;
typedef short bf16x8 __attribute__((ext_vector_type(8)));
typedef float f32x4 __attribute__((ext_vector_type(4)));
typedef unsigned u32x4 __attribute__((ext_vector_type(4)));
constexpr int BM = 256, BK = 64, HALF = 128, HTB = HALF * BK * 2  , STAGE_BYTES = 8 * HTB, NXCD = 8, WGM = 8;

__host__ __device__ __forceinline__ int lds_byte(int r, int c) { const int st = (r >> 4) * 2 + (c >> 5), rr = r & 15, cc = c & 31, ob = rr * 64 + cc * 2; return st * 1024 + (ob ^ (((ob >> 9) & 1) << 5)); }
__host__ __device__ __forceinline__ void stage_rc(int b, int& R, int& C) { const int st = b / 1024, sb = b % 1024, swz = sb ^ (((sb >> 9) & 1) << 5); R = (st >> 1) * 16 + swz / 64; C = (st & 1) * 32 + (swz % 64) / 2; }
__host__ __device__ __forceinline__ int perm32(int rho) { const int n = rho >> 4, i = rho & 15; return 8 * (i >> 2) + 4 * n + (i & 3); }

struct Unit { int pm, pn, aux; };
struct Gemm { const bf16_t* A; const bf16_t* Bt; int M, N, K, lda, ldb; };

struct StaticOrder {
    int nM, nN, nwg, G, c;
    __host__ __device__ void init(int M, int N, int G_, int c_) { nM = M / BM; nN = N / BM; nwg = nM * nN; G = G_; c = c_; }
    __host__ __device__ bool next(int i, Unit& u) const {
        const long L = (long)i * G + c; if (L >= nwg) return false;
        int wgid = (int)L; { const int q = nwg / NXCD, r = nwg % NXCD, xcd = wgid % NXCD, off = wgid / NXCD; wgid = (xcd < r ? xcd * (q + 1) : r * (q + 1) + (xcd - r) * q) + off; }
        const int nig = WGM * nN, gid = wgid / nig, fm = gid * WGM, gsz = (nM - fm) < WGM ? (nM - fm) : WGM;
        u.pm = fm + ((wgid % nig) % gsz); u.pn = (wgid % nig) / gsz; return true;
    }
    __device__ __forceinline__ void a_ready(const Unit&) const {}
    __device__ __forceinline__ void done(const Unit&) const {}
};

__device__ __forceinline__ unsigned cvt_pk_bf16(float lo, float hi) { unsigned r; asm volatile("v_cvt_pk_bf16_f32 %0, %1, %2" : "=v"(r) : "v"(lo), "v"(hi)); return r; }
typedef float f32x2 __attribute__((ext_vector_type(2)));
__device__ __forceinline__ f32x2 gelu_pk(f32x2 v) {
    const f32x2 av = __builtin_elementwise_abs(v), d = av * 0.2316418882f + 1.0f;
    f32x2 t; t.x = __builtin_amdgcn_rcpf(d.x); t.y = __builtin_amdgcn_rcpf(d.y);
    f32x2 q = t * 0.5307027145f + (-0.7265760135f); q = q * t + 0.7107068705f; q = q * t + (-0.142248368f); q = q * t + 0.127414796f; q = q * t;
    const f32x2 s = (v * v) * (-0.72134752044f);
    f32x2 e; e.x = __builtin_amdgcn_exp2f(s.x); e.y = __builtin_amdgcn_exp2f(s.y);
    const f32x2 m = v * (q * e), r = v - m;
    f32x2 o; o.x = v.x < 0.f ? m.x : r.x; o.y = v.y < 0.f ? m.y : r.y; return o;
}

template <int ACT  > struct EpiBf16 {
    static constexpr bool PERM = true, AFTER_DRAIN = false; static constexpr int MID = 0; static_assert(ACT == 0 || ACT == 1, "EpiBf16: ACT is 0 (none) or 1 (gelu_pk)");
    bf16_t* O; int ldc; const float* bias; int split_cols; size_t split_stride; float scale0;
    __device__ __forceinline__ void operator()(const f32x4 (&acc)[2][2][4][2], const Unit& u, int wr, int wc, int fr, int fq) const {
        const int row0 = u.pm * BM + wr * 64 + fr; int colt = u.pn * BM; bf16_t* base = O;
        float sc = scale0; if (split_cols) { const int t = colt / split_cols; base += (size_t)t * split_stride; colt -= t * split_cols; if (t != 0) sc = 1.f; }
        const int col0 = colt + wc * 32 + 8 * fq, bcol0 = u.pn * BM + wc * 32 + 8 * fq;
        f32x4 bv[2][2];
#pragma unroll
        for (int bj = 0; bj < 2; ++bj)
#pragma unroll
            for (int n = 0; n < 2; ++n) bv[bj][n] = bias ? *(const f32x4*)(bias + bcol0 + bj * HALF + 4 * n) : (f32x4){0.f, 0.f, 0.f, 0.f};
#pragma unroll
        for (int ai = 0; ai < 2; ++ai)
#pragma unroll
            for (int m = 0; m < 4; ++m) { bf16_t* rowp = base + (size_t)(row0 + ai * HALF + m * 16) * ldc + col0;
#pragma unroll
                for (int bj = 0; bj < 2; ++bj) { f32x4 v0 = acc[ai][bj][m][0] + bv[bj][0], v1 = acc[ai][bj][m][1] + bv[bj][1];
                    if (ACT == 1) { f32x2 a = gelu_pk((f32x2){v0[0], v0[1]}), b = gelu_pk((f32x2){v0[2], v0[3]}), c = gelu_pk((f32x2){v1[0], v1[1]}), d = gelu_pk((f32x2){v1[2], v1[3]});
                        v0 = (f32x4){a.x, a.y, b.x, b.y}; v1 = (f32x4){c.x, c.y, d.x, d.y}; }
                    v0 = v0 * sc; v1 = v1 * sc; u32x4 w; w.x = cvt_pk_bf16(v0[0], v0[1]); w.y = cvt_pk_bf16(v0[2], v0[3]); w.z = cvt_pk_bf16(v1[0], v1[1]); w.w = cvt_pk_bf16(v1[2], v1[3]);
                    *(u32x4*)(rowp + bj * HALF) = w; } }
    }
};

typedef int i32x8 __attribute__((ext_vector_type(8)));
__device__ __forceinline__ i32x8 cat8(const bf16x8 a, const bf16x8 b) { typedef int i32x4 __attribute__((ext_vector_type(4))); const i32x4 x = __builtin_bit_cast(i32x4, a), y = __builtin_bit_cast(i32x4, b); return (i32x8){x[0], x[1], x[2], x[3], y[0], y[1], y[2], y[3]}; }
__device__ __forceinline__ bf16x8 lo8(const i32x8 v) { typedef int i32x4 __attribute__((ext_vector_type(4))); return __builtin_bit_cast(bf16x8, __builtin_shufflevector(v, v, 0, 1, 2, 3)); }
__device__ __forceinline__ bf16x8 hi8(const i32x8 v) { typedef int i32x4 __attribute__((ext_vector_type(4))); return __builtin_bit_cast(bf16x8, __builtin_shufflevector(v, v, 4, 5, 6, 7)); }
template <class Epi, class Sched, bool ALIGN_EPI = false, bool SP2 = false, bool FP8 = false>
__device__ __forceinline__ void gemm_phase(PG8_LAS unsigned char* lds, const Gemm g, const Sched& S, const Epi& E) {
    const int tid = threadIdx.x, wid = __builtin_amdgcn_readfirstlane(tid >> 6), lane = tid & 63, wr = wid >> 2, wc = wid & 3, fr = lane & 15, fq = lane >> 4;
    const int K = g.K, nt = K / BK;
    unsigned voffA[2], voffB[2];
#pragma unroll
    for (int i = 0; i < 2; ++i) { int R, C; stage_rc(tid * 16 + i * 8192, R, C); const int Rb = Epi::PERM ? ((R & ~31) + perm32(R & 31)) : R;
        voffA[i] = (unsigned)(R * g.lda + C) * 2u; voffB[i] = (unsigned)(Rb * g.ldb + C) * 2u; }
    const size_t kstep = (size_t)(BK * 2);
    const size_t hstepA = (size_t)HALF * g.lda * 2, hstepB = (size_t)HALF * g.ldb * 2;
    const size_t tstepA = 2 * hstepA, tstepB = 2 * hstepB;
    const unsigned ldsw = (unsigned)wid * 1024u;
    const int aoff = lds_byte(wr * 64 + fr, fq * 8), boff = lds_byte(wc * 32 + fr, fq * 8);
#define PG8_SA(b, h) (((b) * 2 + (h)) * HTB)
#define PG8_SB(b, h) ((4 + (b) * 2 + (h)) * HTB)
#define PG8_STAGE(bufoff, gbase, voff) do { _Pragma("unroll") for (int _i = 0; _i < 2; ++_i) \
        __builtin_amdgcn_global_load_lds((const unsigned*)((const char*)(gbase) + (voff)[_i]), (PG8_LAS unsigned*)(lds + (bufoff) + ldsw + _i * 8192), 16, 0, 0); } while (0)
#define PG8_LDA(dst, b, h) do { _Pragma("unroll") for (int m = 0; m < 4; ++m) { if constexpr (FP8) dst##8[m] = cat8(*(const PG8_LAS bf16x8*)(lds + PG8_SA(b, h) + aoff + m * 2048), *(const PG8_LAS bf16x8*)(lds + PG8_SA(b, h) + aoff + m * 2048 + 1024)); \
        else { _Pragma("unroll") for (int k = 0; k < 2; ++k) dst[m][k] = *(const PG8_LAS bf16x8*)(lds + PG8_SA(b, h) + aoff + m * 2048 + k * 1024); } } } while (0)
#define PG8_LDB(dst, b, h) do { _Pragma("unroll") for (int n = 0; n < 2; ++n) { if constexpr (FP8) dst##8[n] = cat8(*(const PG8_LAS bf16x8*)(lds + PG8_SB(b, h) + boff + n * 2048), *(const PG8_LAS bf16x8*)(lds + PG8_SB(b, h) + boff + n * 2048 + 1024)); \
        else { _Pragma("unroll") for (int k = 0; k < 2; ++k) dst[n][k] = *(const PG8_LAS bf16x8*)(lds + PG8_SB(b, h) + boff + n * 2048 + k * 1024); } } } while (0)
#define PG8_MMA(ai, bj, At, Bt) do { __builtin_amdgcn_s_setprio(1); _Pragma("unroll") for (int m = 0; m < 4; ++m) _Pragma("unroll") for (int n = 0; n < 2; ++n) { \
        if constexpr (FP8) asm volatile("v_mfma_scale_f32_16x16x128_f8f6f4 %0, %1, %2, %0, %3, %3 op_sel_hi:[0,0,0]" : "+v"(acc[ai][bj][m][n]) : "v"(Bt##8[n]), "v"(At##8[m]), "v"(fp8_unit_scale)); \
        else { _Pragma("unroll") for (int k = 0; k < 2; ++k) acc[ai][bj][m][n] = __builtin_amdgcn_mfma_f32_16x16x32_bf16(Bt[n][k], At[m][k], acc[ai][bj][m][n], 0, 0, 0); } } __builtin_amdgcn_s_setprio(0); } while (0)
#define PG8_WAIT_V(n) asm volatile("s_waitcnt vmcnt(" #n ")" ::: "memory")
#define PG8_WAIT_L(n) asm volatile("s_waitcnt lgkmcnt(" #n ")" ::: "memory")
#define PG8_BAR __builtin_amdgcn_s_barrier()
#define PG8_SCHED __builtin_amdgcn_sched_barrier(0)
    Unit cur, nxt; int ui = 0;
    if (!S.next(0, cur)) return;
    f32x4 acc[2][2][4][2];
#pragma unroll
    for (int a = 0; a < 2; ++a)
#pragma unroll
        for (int b = 0; b < 2; ++b)
#pragma unroll
            for (int m = 0; m < 4; ++m)
#pragma unroll
                for (int n = 0; n < 2; ++n) acc[a][b][m][n] = (f32x4){0.f, 0.f, 0.f, 0.f};
    int fp8_unit_scale = 0x7F7F7F7F; asm volatile("" : "+v"(fp8_unit_scale));
    bf16x8 At[4][2], B0[2][2], B1[2][2];
    i32x8 At8[4], B08[2], B18[2];
    const char* cA = (const char*)g.A + (size_t)cur.pm * tstepA; const char* cB = (const char*)g.Bt + (size_t)cur.pn * tstepB;
    S.a_ready(cur);
    if constexpr (SP2) {
        PG8_STAGE(PG8_SB(0, 0), cB, voffB); PG8_STAGE(PG8_SB(0, 1), cB + hstepB, voffB); PG8_STAGE(PG8_SA(0, 0), cA, voffA); PG8_STAGE(PG8_SA(0, 1), cA + hstepA, voffA);
        if (wr == 1) PG8_BAR;
        PG8_WAIT_V(2); PG8_BAR;
        PG8_STAGE(PG8_SB(1, 0), cB + kstep, voffB); PG8_STAGE(PG8_SA(1, 0), cA + kstep, voffA); PG8_STAGE(PG8_SB(1, 1), cB + hstepB + kstep, voffB);
        PG8_WAIT_V(6); PG8_BAR;
    } else {
        PG8_STAGE(PG8_SB(0, 0), cB, voffB); PG8_STAGE(PG8_SA(0, 0), cA, voffA); PG8_STAGE(PG8_SB(0, 1), cB + hstepB, voffB); PG8_STAGE(PG8_SA(0, 1), cA + hstepA, voffA);
        if (wr == 1) PG8_BAR;
        PG8_WAIT_V(4); PG8_BAR;
        PG8_STAGE(PG8_SB(1, 0), cB + kstep, voffB); PG8_STAGE(PG8_SA(1, 0), cA + kstep, voffA); PG8_STAGE(PG8_SB(1, 1), cB + hstepB + kstep, voffB);
        PG8_WAIT_V(6); PG8_BAR;
    }
    for (;;) {
        const bool has_next = S.next(ui + 1, nxt);
        const char* nA = has_next ? (const char*)g.A + (size_t)nxt.pm * tstepA : cA; const char* nB = has_next ? (const char*)g.Bt + (size_t)nxt.pn * tstepB : cB;
        for (int t = 0; t < nt; t += 2) {
            const bool last = (t == nt - 2);
            const char* a1 = cA + (size_t)(t + 1) * kstep;
            const char* a2 = last ? nA : cA + (size_t)(t + 2) * kstep; const char* b2 = last ? nB : cB + (size_t)(t + 2) * kstep;
            const char* a3 = a2 + kstep; const char* b3 = b2 + kstep;
            if (last && has_next) S.a_ready(nxt);
            if constexpr (SP2) {
            if constexpr (Epi::MID > 0) { if (t != 0 && (t % Epi::MID) == 0) { PG8_SCHED; if constexpr (FP8) asm volatile("s_nop 7\n\ts_nop 7" ::: "memory"); E.mid(acc, cur, t / Epi::MID, wr, wc, fr, fq); if constexpr (FP8) asm volatile("s_nop 7" ::: "memory"); PG8_SCHED; } }
            PG8_LDB(B0, 0, 0); PG8_LDB(B1, 0, 1); PG8_SCHED; PG8_LDA(At, 0, 0); PG8_STAGE(PG8_SA(1, 1), a1 + hstepA, voffA);
            PG8_WAIT_V(8); PG8_WAIT_L(0); PG8_BAR; PG8_MMA(0, 0, At, B0); PG8_MMA(0, 1, At, B1); PG8_BAR; PG8_SCHED;
            PG8_LDA(At, 0, 1); PG8_STAGE(PG8_SB(0, 0), b2, voffB); PG8_STAGE(PG8_SB(0, 1), b2 + hstepB, voffB); PG8_STAGE(PG8_SA(0, 0), a2, voffA);
            PG8_WAIT_V(8); PG8_WAIT_L(0); PG8_BAR; PG8_MMA(1, 0, At, B0); PG8_MMA(1, 1, At, B1); PG8_BAR; PG8_SCHED;
            PG8_LDB(B0, 1, 0); PG8_LDB(B1, 1, 1); PG8_SCHED; PG8_LDA(At, 1, 0); PG8_STAGE(PG8_SA(0, 1), a2 + hstepA, voffA);
            PG8_WAIT_V(8); PG8_WAIT_L(0); PG8_BAR; PG8_MMA(0, 0, At, B0); PG8_MMA(0, 1, At, B1); PG8_BAR; PG8_SCHED;
            PG8_LDA(At, 1, 1); PG8_STAGE(PG8_SB(1, 0), b3, voffB); PG8_STAGE(PG8_SB(1, 1), b3 + hstepB, voffB); PG8_STAGE(PG8_SA(1, 0), a3, voffA);
            PG8_WAIT_V(8); PG8_WAIT_L(0); PG8_BAR; PG8_MMA(1, 0, At, B0); PG8_MMA(1, 1, At, B1); PG8_BAR; PG8_SCHED;
            } else {
            PG8_LDB(B0, 0, 0); PG8_SCHED; PG8_LDA(At, 0, 0); PG8_STAGE(PG8_SA(1, 1), a1 + hstepA, voffA);
            PG8_WAIT_L(8); PG8_BAR; PG8_WAIT_L(0); PG8_MMA(0, 0, At, B0); PG8_BAR; PG8_SCHED;
            PG8_LDB(B1, 0, 1); PG8_STAGE(PG8_SB(0, 0), b2, voffB);
            PG8_BAR; PG8_WAIT_L(0); PG8_MMA(0, 1, At, B1); PG8_BAR;
            PG8_LDA(At, 0, 1); PG8_STAGE(PG8_SA(0, 0), a2, voffA);
            PG8_BAR; PG8_WAIT_L(0); PG8_MMA(1, 0, At, B0); PG8_BAR; PG8_SCHED;
            PG8_STAGE(PG8_SB(0, 1), b2 + hstepB, voffB);
            PG8_WAIT_V(6); PG8_BAR; PG8_MMA(1, 1, At, B1); PG8_BAR;
            PG8_LDB(B0, 1, 0); PG8_SCHED; PG8_LDA(At, 1, 0); PG8_STAGE(PG8_SA(0, 1), a2 + hstepA, voffA);
            PG8_WAIT_L(8); PG8_BAR; PG8_WAIT_L(0); PG8_MMA(0, 0, At, B0); PG8_BAR; PG8_SCHED;
            PG8_LDB(B1, 1, 1); PG8_STAGE(PG8_SB(1, 0), b3, voffB);
            PG8_BAR; PG8_WAIT_L(0); PG8_MMA(0, 1, At, B1); PG8_BAR;
            PG8_LDA(At, 1, 1); PG8_STAGE(PG8_SA(1, 0), a3, voffA);
            PG8_BAR; PG8_WAIT_L(0); PG8_MMA(1, 0, At, B0); PG8_BAR; PG8_SCHED;
            PG8_STAGE(PG8_SB(1, 1), b3 + hstepB, voffB);
            PG8_WAIT_V(6); PG8_BAR; PG8_MMA(1, 1, At, B1); PG8_BAR;
            }
        }
        if constexpr (ALIGN_EPI) { if (wr == 0) PG8_BAR; }
        if constexpr (FP8) asm volatile("s_nop 7\n\ts_nop 7" ::: "memory");
        if constexpr (!Epi::AFTER_DRAIN) { E(acc, cur, wr, wc, fr, fq); S.done(cur); }
        if (!has_next) break;
#pragma unroll
        for (int a = 0; a < 2; ++a)
#pragma unroll
            for (int b = 0; b < 2; ++b)
#pragma unroll
                for (int m = 0; m < 4; ++m)
#pragma unroll
                    for (int n = 0; n < 2; ++n) acc[a][b][m][n] = (f32x4){0.f, 0.f, 0.f, 0.f};
        cur = nxt; cA = nA; cB = nB; ++ui;
        if constexpr (ALIGN_EPI) { if (wr == 1) PG8_BAR; }
    }
    PG8_WAIT_V(0);
    if constexpr (!ALIGN_EPI) { if (wr == 0) PG8_BAR; }
    PG8_BAR;
    if constexpr (Epi::AFTER_DRAIN) { E.fused(acc, cur, wr, wc, fr, fq, lds, wid, lane); S.done(cur); }
#undef PG8_SA
#undef PG8_SB
#undef PG8_STAGE
#undef PG8_LDA
#undef PG8_LDB
#undef PG8_MMA
#undef PG8_WAIT_V
#undef PG8_WAIT_L
#undef PG8_BAR
#undef PG8_SCHED
}
template <class Epi, class Sched, bool FP8 = false>
__device__ __forceinline__ void gemm_phase_gather(PG8_LAS unsigned char* lds, const Gemm g, const Sched& S, const Epi& E) {
    const int tid = threadIdx.x, wid = __builtin_amdgcn_readfirstlane(tid >> 6), lane = tid & 63, wr = wid >> 2, wc = wid & 3, fr = lane & 15, fq = lane >> 4;
    const int K = g.K, nt = K / BK;
    unsigned voffB[2]; int RA[2], CA[2];
#pragma unroll
    for (int i = 0; i < 2; ++i) { int R, C; stage_rc(tid * 16 + i * 8192, R, C); const int Rb = Epi::PERM ? ((R & ~31) + perm32(R & 31)) : R;
        RA[i] = R; CA[i] = C; voffB[i] = (unsigned)(Rb * g.ldb + C) * 2u; }
    const size_t kstep = (size_t)(BK * 2);
    const size_t hstepB = (size_t)HALF * g.ldb * 2, tstepB = 2 * hstepB;
    const unsigned ldsw = (unsigned)wid * 1024u;
    const int aoff = lds_byte(wr * 64 + fr, fq * 8), boff = lds_byte(wc * 32 + fr, fq * 8);
#define PG8_SA(b, h) (((b) * 2 + (h)) * HTB)
#define PG8_SB(b, h) ((4 + (b) * 2 + (h)) * HTB)
#define PG8_STAGE(bufoff, gbase, voff) do { _Pragma("unroll") for (int _i = 0; _i < 2; ++_i) \
        __builtin_amdgcn_global_load_lds((const unsigned*)((const char*)(gbase) + (voff)[_i]), (PG8_LAS unsigned*)(lds + (bufoff) + ldsw + _i * 8192), 16, 0, 0); } while (0)
#define PG8_LDA(dst, b, h) do { _Pragma("unroll") for (int m = 0; m < 4; ++m) { if constexpr (FP8) dst##8[m] = cat8(*(const PG8_LAS bf16x8*)(lds + PG8_SA(b, h) + aoff + m * 2048), *(const PG8_LAS bf16x8*)(lds + PG8_SA(b, h) + aoff + m * 2048 + 1024)); \
        else { _Pragma("unroll") for (int k = 0; k < 2; ++k) dst[m][k] = *(const PG8_LAS bf16x8*)(lds + PG8_SA(b, h) + aoff + m * 2048 + k * 1024); } } } while (0)
#define PG8_LDB(dst, b, h) do { _Pragma("unroll") for (int n = 0; n < 2; ++n) { if constexpr (FP8) dst##8[n] = cat8(*(const PG8_LAS bf16x8*)(lds + PG8_SB(b, h) + boff + n * 2048), *(const PG8_LAS bf16x8*)(lds + PG8_SB(b, h) + boff + n * 2048 + 1024)); \
        else { _Pragma("unroll") for (int k = 0; k < 2; ++k) dst[n][k] = *(const PG8_LAS bf16x8*)(lds + PG8_SB(b, h) + boff + n * 2048 + k * 1024); } } } while (0)
#define PG8_MMA(ai, bj, At, Bt) do { __builtin_amdgcn_s_setprio(1); _Pragma("unroll") for (int m = 0; m < 4; ++m) _Pragma("unroll") for (int n = 0; n < 2; ++n) { \
        if constexpr (FP8) asm volatile("v_mfma_scale_f32_16x16x128_f8f6f4 %0, %1, %2, %0, %3, %3 op_sel_hi:[0,0,0]" : "+v"(acc[ai][bj][m][n]) : "v"(Bt##8[n]), "v"(At##8[m]), "v"(fp8_unit_scale)); \
        else { _Pragma("unroll") for (int k = 0; k < 2; ++k) acc[ai][bj][m][n] = __builtin_amdgcn_mfma_f32_16x16x32_bf16(Bt[n][k], At[m][k], acc[ai][bj][m][n], 0, 0, 0); } } __builtin_amdgcn_s_setprio(0); } while (0)
#define PG8_WAIT_V(n) asm volatile("s_waitcnt vmcnt(" #n ")" ::: "memory")
#define PG8_WAIT_L(n) asm volatile("s_waitcnt lgkmcnt(" #n ")" ::: "memory")
#define PG8_BAR __builtin_amdgcn_s_barrier()
#define PG8_SCHED __builtin_amdgcn_sched_barrier(0)
#define PG8_ROWS(dst, ui_) do { _Pragma("unroll") for (int _h = 0; _h < 2; ++_h) _Pragma("unroll") for (int _i = 0; _i < 2; ++_i) \
        dst[_h][_i] = (unsigned)S.row_token((ui_), _h * HALF + RA[_i]) * (unsigned)(g.lda * 2) + (unsigned)(CA[_i] * 2); } while (0)
    Unit cur, nxt; int ui = 0;
    if (!S.next(0, cur)) return;
    f32x4 acc[2][2][4][2];
#pragma unroll
    for (int a = 0; a < 2; ++a)
#pragma unroll
        for (int b = 0; b < 2; ++b)
#pragma unroll
            for (int m = 0; m < 4; ++m)
#pragma unroll
                for (int n = 0; n < 2; ++n) acc[a][b][m][n] = (f32x4){0.f, 0.f, 0.f, 0.f};
    int fp8_unit_scale = 0x7F7F7F7F; asm volatile("" : "+v"(fp8_unit_scale));
    bf16x8 At[4][2], B0[2][2], B1[2][2];
    i32x8 At8[4], B08[2], B18[2];
    unsigned offC[2][2];
    PG8_ROWS(offC, 0);
    const char* gA = (const char*)g.A;
    const char* cB = (const char*)g.Bt + (size_t)cur.pn * tstepB;
    PG8_STAGE(PG8_SB(0, 0), cB, voffB); PG8_STAGE(PG8_SB(0, 1), cB + hstepB, voffB); PG8_STAGE(PG8_SA(0, 0), gA, offC[0]); PG8_STAGE(PG8_SA(0, 1), gA, offC[1]);
    if (wr == 1) PG8_BAR;
    PG8_WAIT_V(2); PG8_BAR;
    PG8_STAGE(PG8_SB(1, 0), cB + kstep, voffB); PG8_STAGE(PG8_SA(1, 0), gA + kstep, offC[0]); PG8_STAGE(PG8_SB(1, 1), cB + hstepB + kstep, voffB);
    PG8_WAIT_V(6); PG8_BAR;
    for (;;) {
        const bool has_next = S.next(ui + 1, nxt);
        const char* nB = has_next ? (const char*)g.Bt + (size_t)nxt.pn * tstepB : cB;
        for (int t = 0; t < nt; t += 2) {
            const bool last = (t == nt - 2);
            const char* a1 = gA + (size_t)(t + 1) * kstep;
            const char* a2 = last ? gA : gA + (size_t)(t + 2) * kstep; const char* b2 = last ? nB : cB + (size_t)(t + 2) * kstep;
            const char* a3 = a2 + kstep; const char* b3 = b2 + kstep;
            PG8_LDB(B0, 0, 0); PG8_LDB(B1, 0, 1); PG8_SCHED; PG8_LDA(At, 0, 0); PG8_STAGE(PG8_SA(1, 1), a1, offC[1]);
            if (last && has_next) { PG8_ROWS(offC, ui + 1); }
            PG8_WAIT_V(8); PG8_WAIT_L(0); PG8_BAR; PG8_MMA(0, 0, At, B0); PG8_MMA(0, 1, At, B1); PG8_BAR; PG8_SCHED;
            PG8_LDA(At, 0, 1); PG8_STAGE(PG8_SB(0, 0), b2, voffB); PG8_STAGE(PG8_SB(0, 1), b2 + hstepB, voffB); PG8_STAGE(PG8_SA(0, 0), a2, offC[0]);
            PG8_WAIT_V(8); PG8_WAIT_L(0); PG8_BAR; PG8_MMA(1, 0, At, B0); PG8_MMA(1, 1, At, B1); PG8_BAR; PG8_SCHED;
            PG8_LDB(B0, 1, 0); PG8_LDB(B1, 1, 1); PG8_SCHED; PG8_LDA(At, 1, 0); PG8_STAGE(PG8_SA(0, 1), a2, offC[1]);
            PG8_WAIT_V(8); PG8_WAIT_L(0); PG8_BAR; PG8_MMA(0, 0, At, B0); PG8_MMA(0, 1, At, B1); PG8_BAR; PG8_SCHED;
            PG8_LDA(At, 1, 1); PG8_STAGE(PG8_SB(1, 0), b3, voffB); PG8_STAGE(PG8_SB(1, 1), b3 + hstepB, voffB); PG8_STAGE(PG8_SA(1, 0), a3, offC[0]);
            PG8_WAIT_V(8); PG8_WAIT_L(0); PG8_BAR; PG8_MMA(1, 0, At, B0); PG8_MMA(1, 1, At, B1); PG8_BAR; PG8_SCHED;
        }
        if (wr == 0) PG8_BAR;
        if constexpr (FP8) asm volatile("s_nop 7\n\ts_nop 7" ::: "memory");
        E(acc, cur, wr, wc, fr, fq); S.done(cur);
        if (!has_next) break;
#pragma unroll
        for (int a = 0; a < 2; ++a)
#pragma unroll
            for (int b = 0; b < 2; ++b)
#pragma unroll
                for (int m = 0; m < 4; ++m)
#pragma unroll
                    for (int n = 0; n < 2; ++n) acc[a][b][m][n] = (f32x4){0.f, 0.f, 0.f, 0.f};
        cur = nxt; cB = nB; ++ui;
        if (wr == 1) PG8_BAR;
    }
    PG8_WAIT_V(0);
    PG8_BAR;
#undef PG8_ROWS
#undef PG8_SA
#undef PG8_SB
#undef PG8_STAGE
#undef PG8_LDA
#undef PG8_LDB
#undef PG8_MMA
#undef PG8_WAIT_V
#undef PG8_WAIT_L
#undef PG8_BAR
#undef PG8_SCHED
}
}

#ifndef GATE_FP8
#define GATE_FP8 1
#endif
#ifndef GATE_SPLIT
#define GATE_SPLIT 1
#endif
#ifndef YEXP_FP8
#define YEXP_FP8 1
#endif
#ifndef CONV_SKIP
#define CONV_SKIP 6
#endif
#ifndef MERGE_FP8
#define MERGE_FP8 1
#endif
#ifndef MOE_DN_FP8
#define MOE_DN_FP8 1
#endif
#ifndef MOE_UP_FP8
#define MOE_UP_FP8 1
#endif
#ifndef PROBE_NOATOM
#define PROBE_NOATOM 0
#endif
constexpr int T = 8192, D = 2048, NL = 2, BW = 512, ZC = 14336, INC = 14352;
constexpr int NE = 64, NEX = 65  , ED = 512;
constexpr int BRW = 4 * BW;
constexpr int HK = NEX * ED;
constexpr float ALPHA = 1.41421356237f;
constexpr float LN_EPS = 1e-5f;
constexpr float UPSC = MOE_UP_FP8 ? (1.f / 64.f) : 1.f;
constexpr float BRSC = MERGE_FP8 ? 8.f : 1.f, MGSC = MERGE_FP8 ? (1.f / (8.f * 64.f)) : 1.f;
constexpr float GSC = 8.f;
constexpr float YSC = 64.f;
constexpr float HSC = 8.f, DNSC = MOE_DN_FP8 ? (1.f / (HSC * 64.f)) : 1.f;
constexpr int ZC_SBQ = 0, ZC_SBK = 512, ZC_SBV = 1024, ZC_GMU = 1536, ZC_GMV = 2048, ZC_GDN = 2560, ZC_GDNG = 4096,
              ZC_MLQ = 4608, ZC_MLK = 4864, ZC_MLV = 5120, ZC_MLO = 5632, ZC_GATE = 6144;

#define GAS __attribute__((address_space(1)))
#define LAS __attribute__((address_space(3)))
typedef unsigned short bf16;
typedef unsigned v4u __attribute__((ext_vector_type(4)));
typedef unsigned v2u __attribute__((ext_vector_type(2)));
typedef float v4f __attribute__((ext_vector_type(4)));
typedef float v2f __attribute__((ext_vector_type(2)));
#define LDS_WAIT() asm volatile("s_waitcnt lgkmcnt(0)" ::: "memory")
#define LDS_BAR() do { asm volatile("s_waitcnt lgkmcnt(0)" ::: "memory"); __builtin_amdgcn_s_barrier(); asm volatile("" ::: "memory"); } while (0)

constexpr size_t MiB = 1u << 20;
constexpr size_t WS_CTL = 0, CTL_ZERO_BYTES = 1 * MiB;
constexpr size_t WS_WIN = 2 * MiB, WS_WBR = 58 * MiB, WS_WOUT = 66 * MiB, WS_WUP = 74 * MiB, WS_WDN = 334 * MiB;
constexpr size_t WS_XB = 464 * MiB, WS_SMALL = 496 * MiB, WS_EG = 497 * MiB, WS_BETA = WS_EG + 256 * 1024, WS_COMB = 498 * MiB;
constexpr size_t WS_Z = 500 * MiB, WS_GQ = 724 * MiB, WS_GK = 740 * MiB, WS_GV = 756 * MiB, WS_GO = 772 * MiB, WS_HO = 788 * MiB;
constexpr size_t WS_BR = 804 * MiB, WS_MTMP = 836 * MiB, WS_MSUM = 900 * MiB, WS_Y = 932 * MiB, WS_X1 = 996 * MiB, WS_X1B = 1060 * MiB;
constexpr size_t WS_XCUR = 1092 * MiB, WS_HB = 1156 * MiB, WS_YEXP = 1236 * MiB, WS_LIST = 1524 * MiB, WS_WL = 1526 * MiB, WS_SLOT = 1528 * MiB, WS_MQ = 1530 * MiB, WS_MS = 1534 * MiB, WS_MK = 1538 * MiB, WS_MV = 1542 * MiB, WS_MFL = 1552 * MiB, WS_HDEN = WS_MFL + 65536, WS_VT = 1553 * MiB, WS_END = 1561 * MiB;
constexpr size_t WS_GU = WS_GQ, WS_GNW = WS_GK, WS_GQG = WS_GK + 8 * MiB, WS_GKT = WS_GV, WS_GAT = WS_GV + 8 * MiB, WS_GDL = WS_GV + 12 * MiB;
constexpr int HROWS = 73728;
static_assert(WS_HB + (size_t)HROWS * ED * 2 <= WS_YEXP && WS_YEXP + (size_t)HROWS * D * 2 <= WS_LIST, "ws map (moe)");
static_assert(WS_WIN + (size_t)ZC * D * 2 <= WS_WBR && WS_WUP + (size_t)NEX * 1024 * D * 2 <= WS_WDN && WS_WDN + (size_t)D * HK * 2 <= WS_XB, "ws map (weights)");
static_assert(WS_Z + (size_t)T * ZC * 2 <= WS_GQ, "ws map (acts)");
constexpr int CW_BAR = 4096, CW_CNT = 16384;
constexpr int TAB_OFF = 131072 + 1024;
constexpr int LDS_BYTES = 163840, MISC_OFF = 131072 + 320;

__device__ __forceinline__ float bflo(unsigned w) { return __uint_as_float(w << 16); }
__device__ __forceinline__ float bfhi(unsigned w) { return __uint_as_float(w & 0xffff0000u); }
__device__ __forceinline__ unsigned f2bf(float f) { unsigned u = __float_as_uint(f); return (u + 0x7fffu + ((u >> 16) & 1u)) >> 16; }
typedef __bf16 bf16n2 __attribute__((ext_vector_type(2))); typedef float f32n2 __attribute__((ext_vector_type(2)));
__device__ __forceinline__ unsigned pk2(float lo, float hi) { const bf16n2 v = __builtin_convertvector((f32n2){lo, hi}, bf16n2); return __builtin_bit_cast(unsigned, v); }
__device__ __forceinline__ unsigned pk4_f8(float a, float b, float c, float d, float sc) {
    a = __builtin_amdgcn_fmed3f(a * sc, -448.f, 448.f); b = __builtin_amdgcn_fmed3f(b * sc, -448.f, 448.f); c = __builtin_amdgcn_fmed3f(c * sc, -448.f, 448.f); d = __builtin_amdgcn_fmed3f(d * sc, -448.f, 448.f);
    unsigned w = 0; w = __builtin_amdgcn_cvt_pk_fp8_f32(a, b, w, false); w = __builtin_amdgcn_cvt_pk_fp8_f32(c, d, w, true); return w; }
__device__ __forceinline__ v4f ld4(const void* base, size_t idx, bool is_bf16) {
    if (is_bf16) { const v2u r = *(const v2u*)((const unsigned short*)base + idx); return (v4f){bflo(r.x), bfhi(r.x), bflo(r.y), bfhi(r.y)}; }
    return *(const v4f*)((const float*)base + idx); }
template <int CTRL> __device__ __forceinline__ float dpp(float x) { return __builtin_bit_cast(float, __builtin_amdgcn_mov_dpp(__builtin_bit_cast(int, x), CTRL, 0xf, 0xf, true)); }
__device__ __forceinline__ float sum4(float x) { x += dpp<0xB1>(x); x += dpp<0x4E>(x); return x; }
__device__ __forceinline__ float sum8(float x) { x = sum4(x); x += dpp<0x141>(x); return x; }
__device__ __forceinline__ float sum16(float x) { x = sum8(x); x += dpp<0x140>(x); return x; }
__device__ __forceinline__ float wave_sum(float x) { x = sum16(x); x += __shfl_xor(x, 16); x += __shfl_xor(x, 32); return x; }
__device__ __forceinline__ float max8(float x) { x = fmaxf(x, dpp<0xB1>(x)); x = fmaxf(x, dpp<0x4E>(x)); x = fmaxf(x, dpp<0x141>(x)); return x; }
__device__ __forceinline__ float min8(float x) { x = fminf(x, dpp<0xB1>(x)); x = fminf(x, dpp<0x4E>(x)); x = fminf(x, dpp<0x141>(x)); return x; }
__device__ __forceinline__ float wave_scan_incl(float v) {
    v += __builtin_bit_cast(float, __builtin_amdgcn_update_dpp(0, __builtin_bit_cast(int, v), 0x111, 0xf, 0xf, true));
    v += __builtin_bit_cast(float, __builtin_amdgcn_update_dpp(0, __builtin_bit_cast(int, v), 0x112, 0xf, 0xf, true));
    v += __builtin_bit_cast(float, __builtin_amdgcn_update_dpp(0, __builtin_bit_cast(int, v), 0x114, 0xf, 0xf, true));
    v += __builtin_bit_cast(float, __builtin_amdgcn_update_dpp(0, __builtin_bit_cast(int, v), 0x118, 0xf, 0xf, true));
    v += __builtin_bit_cast(float, __builtin_amdgcn_update_dpp(0, __builtin_bit_cast(int, v), 0x142, 0xa, 0xf, false));
    v += __builtin_bit_cast(float, __builtin_amdgcn_update_dpp(0, __builtin_bit_cast(int, v), 0x143, 0xc, 0xf, false));
    return v;
}
__device__ __forceinline__ float sigmoidf_(float x) { return __builtin_amdgcn_rcpf(1.f + __expf(-x)); }
__device__ __forceinline__ float sigmoid_div(float x) { return 1.f / (1.f + __expf(-x)); }
__device__ __forceinline__ float siluf_(float x) { return x * __builtin_amdgcn_rcpf(1.f + __expf(-x)); }
__device__ __forceinline__ float softplusf_(float x) { return fmaxf(x, 0.f) + __logf(1.f + __expf(-fabsf(x))); }
__device__ __forceinline__ float gelu_tanh(float x) { const float y = 0.7978845608f * (x + 0.044715f * x * x * x); const float t = 1.f - 2.f * __builtin_amdgcn_rcpf(__expf(2.f * y) + 1.f); return 0.5f * x * (1.f + t); }
__device__ __forceinline__ void unpack8(const v4u r, float (&f)[8]) { f[0] = bflo(r.x); f[1] = bfhi(r.x); f[2] = bflo(r.y); f[3] = bfhi(r.y); f[4] = bflo(r.z); f[5] = bfhi(r.z); f[6] = bflo(r.w); f[7] = bfhi(r.w); }
#define XB_TMO      128
#define XB_XCNT(j)  (256  + 64 * (j))
#define XB_XSUB(j)  (1280 + 64 * (j))
#define XB_XGEN(j)  (2304 + 64 * (j))
#define XB_TOP      3328
#define XB_TOPGEN   3392
#define XCD_BAR_WORDS 3456
#define XB_SPIN_CAP (1u << 18)

__device__ __forceinline__ unsigned xb_ld(unsigned* p)              { return __hip_atomic_load(p, __ATOMIC_RELAXED, __HIP_MEMORY_SCOPE_AGENT); }
__device__ __forceinline__ unsigned xb_add(unsigned* p, unsigned v) { return __hip_atomic_fetch_add(p, v, __ATOMIC_RELAXED, __HIP_MEMORY_SCOPE_AGENT); }
__device__ __forceinline__ unsigned xb_xcc_id() { return (unsigned)__builtin_amdgcn_s_getreg((3 << 11) | 20) & 0xFu; }
#define XB_SPIN(cond, bar) do { unsigned _sp = 0; while (cond) { __builtin_amdgcn_s_sleep(1); \
    if ((++_sp & 255u) == 0u) { if (xb_ld(&(bar)[XB_TMO])) break; if (_sp > XB_SPIN_CAP) { atomicAdd(&(bar)[XB_TMO], 1u); break; } } } } while (0)

struct XcdBarrier {
    unsigned* bar; unsigned x;
    volatile LAS unsigned* st;
};

__device__ __forceinline__ XcdBarrier xcd_barrier_post(unsigned* bar, volatile LAS unsigned* st) {
    XcdBarrier b; b.bar = bar; b.x = xb_xcc_id(); b.st = st;
    if (threadIdx.x == 0) (void)xb_add(&bar[XB_XCNT(b.x)], 1u);
    return b;
}
__device__ __forceinline__ void xcd_barrier_complete(unsigned* bar, unsigned x, unsigned& nloc, unsigned& nx) {
    const unsigned G = gridDim.x * gridDim.y * gridDim.z;
    unsigned sum, cnt, mine, sp = 0u;
    for (;;) {
        sum = 0u; cnt = 0u; mine = 0u;
#pragma unroll
        for (unsigned j = 0; j < 16; ++j) { const unsigned c = xb_ld(&bar[XB_XCNT(j)]); sum += c; cnt += (c > 0u) ? 1u : 0u; mine = (j == x) ? c : mine; }
        if (sum == G) break;
        __builtin_amdgcn_s_sleep(1);
        if ((++sp & 255u) == 0u) { if (xb_ld(&bar[XB_TMO])) break; if (sp > XB_SPIN_CAP) { atomicAdd(&bar[XB_TMO], 1u); break; } }
    }
    nloc = mine > 0u ? mine : 1u; nx = cnt > 0u ? cnt : 1u;
}

__device__ __forceinline__ void xcd_barrier(const XcdBarrier& b) {
    asm volatile("s_waitcnt vmcnt(0)" ::: "memory");
    __syncthreads();
    if (threadIdx.x == 0) {
        unsigned* bar = b.bar;
        __builtin_amdgcn_s_waitcnt(0);
        unsigned nloc = b.st[0], nx = b.st[1];
        if (nloc == 0u) { xcd_barrier_complete(bar, b.x, nloc, nx); b.st[0] = nloc; b.st[1] = nx; }
        const unsigned old = xb_add(&bar[XB_XSUB(b.x)], 1u);
        const unsigned gen = old / nloc;
        if (old + 1u == (gen + 1u) * nloc) {
            __builtin_amdgcn_fence(__ATOMIC_RELEASE, "agent");
            asm volatile("s_waitcnt vmcnt(0)" ::: "memory");
            const unsigned og = xb_add(&bar[XB_TOP], 1u);
            const unsigned tg = og / nx;
            if (og + 1u == (tg + 1u) * nx) xb_add(&bar[XB_TOPGEN], 1u);
            else XB_SPIN(xb_ld(&bar[XB_TOPGEN]) == tg, bar);
            __builtin_amdgcn_fence(__ATOMIC_ACQUIRE, "agent");
            xb_add(&bar[XB_XGEN(b.x)], 1u);
            asm volatile("s_waitcnt vmcnt(0)" ::: "memory");
        } else {
            XB_SPIN(xb_ld(&bar[XB_XGEN(b.x)]) == gen, bar);
            __builtin_amdgcn_fence(__ATOMIC_ACQUIRE, "agent");
            asm volatile("s_waitcnt vmcnt(0)" ::: "memory");
        }
    }
    __syncthreads();
}

struct Params { const float* in[27]; float* out; unsigned char* ws; int ph_lo, ph_hi; };
enum { I_X = 0, I_WIN, I_GMNG, I_GMNB, I_GMWS, I_GMBS, I_CONVW, I_ALOG, I_DTB, I_GDNNG, I_MLIB, I_MLFB, I_MLNG, I_WBR, I_WOUT, I_LN1G, I_LN1B,
       I_WR, I_RB, I_WG, I_WU, I_WD, I_SG, I_SU, I_SD, I_LN2G, I_LN2B };

using pg8::f32x4; using pg8::u32x4; using pg8::Unit; using pg8::HALF; using pg8::BM;

struct EpiGate8 {
    static constexpr bool PERM = true, AFTER_DRAIN = false; static constexpr int MID = 0;
    unsigned char* ZG; float sc;
    __device__ __forceinline__ void operator()(const f32x4 (&acc)[2][2][4][2], const Unit& u, int wr, int wc, int fr, int fq) const {
        const int row0 = u.pm * BM + wr * 64 + fr, col0 = u.pn * BM - ZC_GATE + wc * 32 + 8 * fq; const float k = sc * GSC;
#pragma unroll
        for (int ai = 0; ai < 2; ++ai)
#pragma unroll
            for (int m = 0; m < 4; ++m)
#pragma unroll
                for (int bj = 0; bj < 2; ++bj) { const f32x4 v0 = acc[ai][bj][m][0], v1 = acc[ai][bj][m][1];
                    *(v2u*)(ZG + (size_t)(row0 + ai * HALF + m * 16) * (4 * D) + col0 + bj * HALF) = (v2u){pk4_f8(v0[0], v0[1], v0[2], v0[3], k), pk4_f8(v1[0], v1[1], v1[2], v1[3], k)}; }
    }
};
struct EpiMergeH {
    static constexpr bool PERM = true, AFTER_DRAIN = false; static constexpr int MID = MERGE_FP8 ? BW / (2 * pg8::BK) : BW / pg8::BK;
    const bf16* Z; bf16* msum;
    __device__ __forceinline__ void mid(f32x4 (&acc)[2][2][4][2], const Unit& u, int j, int wr, int wc, int fr, int fq) const {
        int row0 = u.pm * BM + wr * 64 + fr; const int col0 = u.pn * BM + wc * 32 + 8 * fq; asm volatile("" : "+v"(row0));
#if GATE_FP8
        const unsigned char* zp = (const unsigned char*)Z + (size_t)(j - 1) * D + col0;
#else
        const bf16* zp = Z + ZC_GATE + (size_t)(j - 1) * D + col0;
#endif
#if GATE_FP8
        v2u ga[2][2][2], gb[2][2][2];
#else
        v4u ga[2][2][2], gb[2][2][2];
#endif
#if GATE_FP8
#define MH_LD1(buf, m, bj, ai_, m0_) do { const unsigned char* q = zp + (size_t)(row0 + ai_ * HALF + (m0_ + m) * 16) * (4 * D) + bj * HALF; ga[buf][m][bj] = *(const v2u*)q; gb[buf][m][bj] = *(const v2u*)(q + D); } while (0)
#define MH_UNPK(w, f) do { const auto _l0 = __builtin_amdgcn_cvt_pk_f32_fp8(w.x, false), _h0 = __builtin_amdgcn_cvt_pk_f32_fp8(w.x, true), _l1 = __builtin_amdgcn_cvt_pk_f32_fp8(w.y, false), _h1 = __builtin_amdgcn_cvt_pk_f32_fp8(w.y, true); \
        f[0] = _l0[0] * (1.f / GSC); f[1] = _l0[1] * (1.f / GSC); f[2] = _h0[0] * (1.f / GSC); f[3] = _h0[1] * (1.f / GSC); f[4] = _l1[0] * (1.f / GSC); f[5] = _l1[1] * (1.f / GSC); f[6] = _h1[0] * (1.f / GSC); f[7] = _h1[1] * (1.f / GSC); } while (0)
#else
#define MH_LD1(buf, m, bj, ai_, m0_) do { const bf16* q = zp + (size_t)(row0 + ai_ * HALF + (m0_ + m) * 16) * ZC + bj * HALF; ga[buf][m][bj] = *(const v4u*)q; gb[buf][m][bj] = *(const v4u*)(q + D); } while (0)
#define MH_UNPK(w, f) unpack8(w, f)
#endif
#define MH_LOAD(buf, am_) do { const int ai_ = (am_) >> 1, m0_ = ((am_) & 1) * 2; _Pragma("unroll") for (int m = 0; m < 2; ++m) _Pragma("unroll") for (int bj = 0; bj < 2; ++bj) { \
            MH_LD1(buf, m, bj, ai_, m0_); } } while (0)
#define MH_APPLY(buf, am_) do { const int ai_ = (am_) >> 1, m0_ = ((am_) & 1) * 2; _Pragma("unroll") for (int m = 0; m < 2; ++m) _Pragma("unroll") for (int bj = 0; bj < 2; ++bj) { float a[8], b[8]; MH_UNPK(ga[buf][m][bj], a); MH_UNPK(gb[buf][m][bj], b); \
            _Pragma("unroll") for (int i = 0; i < 8; ++i) { const float ea = __builtin_amdgcn_exp2f(fmaxf(a[i], -60.f) * -1.44269504f), eb = __builtin_amdgcn_exp2f(fmaxf(b[i], -60.f) * -1.44269504f); \
                acc[ai_][bj][m0_ + m][i >> 2][i & 3] *= (1.f + eb) * __builtin_amdgcn_rcpf(1.f + ea); } } } while (0)
        MH_LOAD(0, 0); MH_LOAD(1, 1); asm volatile("" ::: "memory");
        MH_APPLY(0, 0); asm volatile("" ::: "memory"); MH_LOAD(0, 2); asm volatile("" ::: "memory");
        MH_APPLY(1, 1); asm volatile("" ::: "memory"); MH_LOAD(1, 3); asm volatile("" ::: "memory");
        MH_APPLY(0, 2); asm volatile("" ::: "memory");
        MH_APPLY(1, 3); asm volatile("" ::: "memory");
#undef MH_LOAD
#undef MH_APPLY
#undef MH_LD1
    }
    __device__ __forceinline__ void operator()(const f32x4 (&acc)[2][2][4][2], const Unit& u, int wr, int wc, int fr, int fq) const {
        const int row0 = u.pm * BM + wr * 64 + fr, col0 = u.pn * BM + wc * 32 + 8 * fq;
#pragma unroll
#if GATE_FP8
        for (int ai = 0; ai < 2; ++ai) { v2u gg[4][2];
#pragma unroll
            for (int m = 0; m < 4; ++m)
#pragma unroll
                for (int bj = 0; bj < 2; ++bj) gg[m][bj] = *(const v2u*)((const unsigned char*)Z + (size_t)(row0 + ai * HALF + m * 16) * (4 * D) + 3 * D + col0 + bj * HALF);
#else
        for (int ai = 0; ai < 2; ++ai) { v4u gg[4][2];
#pragma unroll
            for (int m = 0; m < 4; ++m)
#pragma unroll
                for (int bj = 0; bj < 2; ++bj) gg[m][bj] = *(const v4u*)(Z + (size_t)(row0 + ai * HALF + m * 16) * ZC + ZC_GATE + 3 * D + col0 + bj * HALF);
#endif
#pragma unroll
            for (int m = 0; m < 4; ++m)
#pragma unroll
                for (int bj = 0; bj < 2; ++bj) { const size_t row = (size_t)(row0 + ai * HALF + m * 16); const int col = col0 + bj * HALF; float gl[8]; MH_UNPK(gg[m][bj], gl);
                    f32x4 v0 = acc[ai][bj][m][0], v1 = acc[ai][bj][m][1];
#pragma unroll
                    for (int j = 0; j < 4; ++j) { v0[j] *= sigmoidf_(gl[j]) * MGSC; v1[j] *= sigmoidf_(gl[4 + j]) * MGSC; }
                    unsigned w0 = 0, w1 = 0; w0 = __builtin_amdgcn_cvt_pk_fp8_f32(v0[0], v0[1], w0, false); w0 = __builtin_amdgcn_cvt_pk_fp8_f32(v0[2], v0[3], w0, true); w1 = __builtin_amdgcn_cvt_pk_fp8_f32(v1[0], v1[1], w1, false); w1 = __builtin_amdgcn_cvt_pk_fp8_f32(v1[2], v1[3], w1, true);
                    *(v2u*)((unsigned char*)msum + row * D + col) = (v2u){w0, w1}; }
            asm volatile("" ::: "memory"); }
    }
};
struct EpiResid {
    static constexpr bool PERM = true, AFTER_DRAIN = false; static constexpr int MID = 0;
    const void* X; bf16* Y; float sc; bool xbf;
    __device__ __forceinline__ void operator()(const f32x4 (&acc)[2][2][4][2], const Unit& u, int wr, int wc, int fr, int fq) const {
        const int row0 = u.pm * BM + wr * 64 + fr, col0 = u.pn * BM + wc * 32 + 8 * fq;
#pragma unroll
        for (int ai = 0; ai < 2; ++ai)
#pragma unroll
            for (int m = 0; m < 4; ++m) { const size_t off = (size_t)(row0 + ai * HALF + m * 16) * D + col0;
#pragma unroll
                for (int bj = 0; bj < 2; ++bj) { const f32x4 x0 = ld4(X, off + bj * HALF, xbf), x1 = ld4(X, off + bj * HALF + 4, xbf);
                    const f32x4 v0 = x0 * ALPHA + acc[ai][bj][m][0] * sc, v1 = x1 * ALPHA + acc[ai][bj][m][1] * sc;
                    u32x4 w; w.x = pk2(v0[0], v0[1]); w.y = pk2(v0[2], v0[3]); w.z = pk2(v1[0], v1[1]); w.w = pk2(v1[2], v1[3]); *(u32x4*)(Y + off + bj * HALF) = w; } }
    }
};
struct MoeTab {
    LAS int* t; LAS unsigned short* tok; LAS float* wt; LAS unsigned char* mte;
    __device__ __forceinline__ MoeTab(LAS unsigned char* lds) : t((LAS int*)(lds + TAB_OFF)), tok((LAS unsigned short*)(lds + TAB_OFF + 1024)), wt((LAS float*)(lds + TAB_OFF + 5120)), mte((LAS unsigned char*)(lds + TAB_OFF + 13312)) {}
};
__device__ __forceinline__ void moe_tables(const MoeTab& M, const unsigned* cnt  , int tid, int lane, int wave) {
    __syncthreads();
    if (wave == 0) { const int c = (int)cnt[64 * lane]; const int tiles = (c + 255) >> 8; const float incl = wave_scan_incl((float)tiles);
        M.t[80 + lane] = c; M.t[lane] = (int)incl - tiles; if (lane == 63) { M.t[64] = (int)incl; M.t[65] = (int)incl + T / 256; M.t[80 + 64] = T; } }
    __syncthreads();
    const int Mt = M.t[65];
    for (int mt = tid; mt < Mt; mt += 512) { int e = 0;
        for (int k = 1; k <= 64; ++k) e = (M.t[k] <= mt) ? k : e;
        M.mte[mt] = (unsigned char)e; }
    __syncthreads();
}
struct UpOrder {
    MoeTab M; int n;
    __device__ __forceinline__ bool next(int i, Unit& u) const { if (i >= n) return false; u.pm = M.t[168 + i]; u.pn = M.t[176 + i]; u.aux = i; return true; }
    __device__ __forceinline__ int row_token(int i, int r) const { return (int)M.tok[i * 256 + r]; }
    __device__ __forceinline__ void a_ready(const Unit&) const {}
    __device__ __forceinline__ void done(const Unit&) const {}
};
__device__ __forceinline__ int up_order_build(const MoeTab& M, const int* LIST, const float* WL, int wg, int G, int tid) {
    const int U = 4 * M.t[65];
    if (tid < 8) { const int L = tid * G + wg; if (L < U) { const int mt = L >> 2, q = L & 3, e = M.mte[mt]; M.t[168 + tid] = mt; M.t[176 + tid] = e * 4 + q; M.t[184 + tid] = e; M.t[192 + tid] = mt - M.t[e]; } }
    int n = 0;
#pragma unroll
    for (int i = 0; i < 8; ++i) n += (i * G + wg < U) ? 1 : 0;
    __syncthreads();
    for (int idx = tid; idx < n * 256; idx += 512) { const int i = idx >> 8, r = idx & 255, e = M.t[184 + i], li = M.t[192 + i] * 256 + r;
        int tk = 0; float w = 0.f;
        if (e < NE) { if (li < M.t[80 + e]) { tk = LIST[e * T + li]; w = WL[e * T + li]; } } else { tk = li; w = 1.f; }
        M.tok[idx] = (unsigned short)tk; M.wt[idx] = w; }
    __syncthreads();
    return n;
}
struct EpiGluSparse {
    static constexpr bool PERM = true, AFTER_DRAIN = false; static constexpr int MID = 0;
    LAS const float* wt; bf16* H;
    __device__ __forceinline__ void operator()(const f32x4 (&acc)[2][2][4][2], const Unit& u, int wr, int wc, int fr, int fq) const {
        const int q = u.pn & 3; const int rl0 = wr * 64 + fr, col0 = q * 128 + wc * 32 + 8 * fq;
#pragma unroll
        for (int ai = 0; ai < 2; ++ai)
#pragma unroll
            for (int m = 0; m < 4; ++m) { const int rl = rl0 + ai * HALF + m * 16; const float c = wt[u.aux * 256 + rl]; float h[8];
#pragma unroll
                for (int n = 0; n < 2; ++n)
#pragma unroll
                    for (int j = 0; j < 4; ++j) h[4 * n + j] = siluf_(acc[ai][0][m][n][j] * UPSC) * (acc[ai][1][m][n][j] * UPSC) * c;
#if MOE_DN_FP8
#pragma unroll
                for (int j = 0; j < 8; ++j) h[j] = __builtin_amdgcn_fmed3f(h[j] * HSC, -448.f, 448.f);
                unsigned w0 = 0, w1 = 0; w0 = __builtin_amdgcn_cvt_pk_fp8_f32(h[0], h[1], w0, false); w0 = __builtin_amdgcn_cvt_pk_fp8_f32(h[2], h[3], w0, true); w1 = __builtin_amdgcn_cvt_pk_fp8_f32(h[4], h[5], w1, false); w1 = __builtin_amdgcn_cvt_pk_fp8_f32(h[6], h[7], w1, true);
                *(v2u*)((unsigned char*)H + ((size_t)u.pm * 256 + rl) * ED + col0) = (v2u){w0, w1}; }
#else
                u32x4 w; w.x = pk2(h[0], h[1]); w.y = pk2(h[2], h[3]); w.z = pk2(h[4], h[5]); w.w = pk2(h[6], h[7]);
                *(u32x4*)(H + ((size_t)u.pm * 256 + rl) * ED + col0) = w; }
#endif
    }
};
struct DownOrder {
    MoeTab M; int G, c, U;
    __device__ __forceinline__ bool next(int i, Unit& u) const { const int L = i * G + c; if (L >= U) return false; const int mt = L >> 3, e = (int)M.mte[mt]; u.pm = mt; u.pn = e * 8 + (L & 7); const int left = M.t[80 + e] - 256 * (mt - M.t[e]); u.aux = left < 256 ? left : 256; return true; }
    __device__ __forceinline__ void a_ready(const Unit&) const {}
    __device__ __forceinline__ void done(const Unit&) const {}
};
struct EpiYexp {
    static constexpr bool PERM = true, AFTER_DRAIN = false; static constexpr int MID = 0;
    bf16* Y;
    __device__ __forceinline__ void operator()(const f32x4 (&acc)[2][2][4][2], const Unit& u, int wr, int wc, int fr, int fq) const {
        const int row0 = u.pm * BM + wr * 64 + fr, col0 = (u.pn & 7) * BM + wc * 32 + 8 * fq;
#pragma unroll
        for (int ai = 0; ai < 2; ++ai)
#pragma unroll
            for (int m = 0; m < 4; ++m) { bf16* rowp = Y + (size_t)(row0 + ai * HALF + m * 16) * D + col0;
                if (wr * 64 + fr + ai * HALF + m * 16 >= u.aux) continue;
#pragma unroll
                for (int bj = 0; bj < 2; ++bj) { const f32x4 v0 = acc[ai][bj][m][0] * DNSC, v1 = acc[ai][bj][m][1] * DNSC;
#if YEXP_FP8
                    *(v2u*)((unsigned char*)Y + (size_t)(row0 + ai * HALF + m * 16) * D + col0 + bj * HALF) = (v2u){pk4_f8(v0[0], v0[1], v0[2], v0[3], YSC), pk4_f8(v1[0], v1[1], v1[2], v1[3], YSC)}; } }
#else
                    u32x4 w; w.x = pk2(v0[0], v0[1]); w.y = pk2(v0[2], v0[3]); w.z = pk2(v1[0], v1[1]); w.w = pk2(v1[2], v1[3]); *(u32x4*)(rowp + bj * HALF) = w; } }
#endif
    }
};

struct TrItem { const float* src; bf16* dst; unsigned sld, dld; int f8; };
__device__ __forceinline__ void tr_load(const TrItem& t, int lane, v4f (&v)[8]) { const int r8 = lane >> 3, c4 = lane & 7;
#pragma unroll
    for (int i = 0; i < 8; ++i) v[i] = __builtin_nontemporal_load((const v4f*)(t.src + (size_t)(8 * i + r8) * t.sld + 4 * c4)); }
__device__ __forceinline__ void tr_store(const TrItem& t, const v4f (&v)[8], LAS float* scr, int lane, bool nostore = false) {
    { const int r8 = lane >> 3, c4 = lane & 7;
#pragma unroll
      for (int i = 0; i < 8; ++i) { LAS float* d = scr + (8 * i + r8) * 33 + 4 * c4; d[0] = v[i].x; d[1] = v[i].y; d[2] = v[i].z; d[3] = v[i].w; } }
    LDS_WAIT(); asm volatile("" ::: "memory");
    if (nostore) return;
    if (t.f8) {
        const int c = lane & 3;
#pragma unroll
        for (int j = 0; j < 2; ++j) { const int n = (lane >> 2) + 16 * j; const LAS float* s = scr + (16 * c) * 33 + n; unsigned w[4];
#pragma unroll
            for (int q = 0; q < 4; ++q) { unsigned x = 0; x = __builtin_amdgcn_cvt_pk_fp8_f32(s[(4 * q) * 33] * 64.f, s[(4 * q + 1) * 33] * 64.f, x, false); x = __builtin_amdgcn_cvt_pk_fp8_f32(s[(4 * q + 2) * 33] * 64.f, s[(4 * q + 3) * 33] * 64.f, x, true); w[q] = x; }
            __builtin_nontemporal_store((v4u){w[0], w[1], w[2], w[3]}, (v4u*)((unsigned char*)t.dst + (size_t)n * t.dld + 16 * c)); }
    } else {
        const int c = lane & 7;
#pragma unroll
        for (int j = 0; j < 4; ++j) { const int n = (lane >> 3) + 8 * j; const LAS float* s = scr + (8 * c) * 33 + n;
            v4u o; o.x = pk2(s[0 * 33], s[1 * 33]); o.y = pk2(s[2 * 33], s[3 * 33]); o.z = pk2(s[4 * 33], s[5 * 33]); o.w = pk2(s[6 * 33], s[7 * 33]);
            __builtin_nontemporal_store(o, (v4u*)(t.dst + (size_t)n * t.dld + 8 * c)); }
    }
    LDS_WAIT(); asm volatile("" ::: "memory");
}
template <int PART> __device__ __forceinline__ TrItem tr_decode(const Params& p, int l, int it) {
    unsigned char* ws = p.ws;
    constexpr int N_IN = (ZC / 32) * (D / 64), N_BR = 4 * (BW / 64) * (D / 32), N_OUT = (D / 64) * (D / 32), N_UP = NEX * 2 * (D / 64) * (ED / 32);
    int r = it; TrItem t; t.f8 = 0;
    if (PART == 0) {
        const float* w_in = p.in[I_WIN] + (size_t)l * D * INC; const float* w_br = p.in[I_WBR] + (size_t)l * 4 * BW * D; const float* w_out = p.in[I_WOUT] + (size_t)l * D * D;
        bf16* WIN = (bf16*)(ws + WS_WIN); bf16* WBR = (bf16*)(ws + WS_WBR); bf16* WOUT = (bf16*)(ws + WS_WOUT);
        if (r < N_IN) { const int kb = r / (ZC / 32), n0 = (r % (ZC / 32)) * 32, k0 = kb * 64; const int sc = n0 + (n0 >= ZC_GATE ? 16 : (n0 >= ZC_MLQ ? 8 : 0));
            t.src = w_in + (size_t)k0 * INC + sc; t.sld = INC; t.dst = (bf16*)((unsigned char*)WIN + (size_t)n0 * D + k0); t.dld = D; t.f8 = 1; return t; } r -= N_IN;
        if (r < N_BR) { const int g = r / 512, rr = r % 512, k0 = (rr / 64) * 64, n0 = (rr % 64) * 32;
            t.src = w_br + ((size_t)g * BW + k0) * D + n0; t.sld = D;
#if MERGE_FP8
            t.dst = (bf16*)((unsigned char*)WBR + (size_t)n0 * BRW + g * BW + k0); t.dld = BRW; t.f8 = 1; return t; }
#else
            t.dst = WBR + (size_t)n0 * BRW + g * BW + k0; t.dld = BRW; return t; }
#endif
        r -= N_BR;
        { const int k0 = (r / 64) * 64, n0 = (r % 64) * 32; t.src = w_out + (size_t)k0 * D + n0; t.sld = D; t.dst = (bf16*)((unsigned char*)WOUT + (size_t)n0 * D + k0); t.dld = D; t.f8 = 1; return t; }
    } else {
        const float* w_g = p.in[I_WG] + (size_t)l * NE * D * ED; const float* w_u = p.in[I_WU] + (size_t)l * NE * D * ED; const float* w_d = p.in[I_WD] + (size_t)l * NE * ED * D;
        const float* s_g = p.in[I_SG] + (size_t)l * D * ED; const float* s_u = p.in[I_SU] + (size_t)l * D * ED; const float* s_d = p.in[I_SD] + (size_t)l * ED * D;
        bf16* WUP = (bf16*)(ws + WS_WUP); bf16* WDN = (bf16*)(ws + WS_WDN);
        if (r < N_UP) { const int e = r / 1024, rr = r % 1024, mat = rr / 512, r2 = rr % 512, k0 = (r2 / 16) * 64, n0 = (r2 % 16) * 32;
            const float* sb = (e < NE) ? ((mat ? w_u : w_g) + (size_t)e * D * ED) : (mat ? s_u : s_g);
            const int drow = e * 1024 + (n0 / 128) * 256 + mat * 128 + (n0 % 128);
            t.src = sb + (size_t)k0 * ED + n0; t.sld = ED;
#if MOE_UP_FP8
            t.dst = (bf16*)((unsigned char*)WUP + (size_t)drow * D + k0); t.dld = D; t.f8 = 1; return t; }
#else
            t.dst = WUP + (size_t)drow * D + k0; t.dld = D; return t; }
#endif
        r -= N_UP;
        { const int e = r / 512, rr = r % 512, k0 = (rr / 64) * 64, n0 = (rr % 64) * 32;
            const float* sb = (e < NE) ? (w_d + (size_t)e * ED * D) : s_d;
            t.src = sb + (size_t)k0 * D + n0; t.sld = D;
#if MOE_DN_FP8
            t.dst = (bf16*)((unsigned char*)WDN + ((size_t)e * D + n0) * ED + k0); t.dld = ED; t.f8 = 1; return t; }
#else
            t.dst = WDN + ((size_t)e * D + n0) * ED + k0; t.dld = ED; return t; }
#endif
    }
}
template <int PART> __device__ __forceinline__ void phase_convert(const Params& p, int l, LAS unsigned char* lds, int gw, int NGW, int wave, int lane, bool nostore = false, int lo = 0, int hi = 1 << 30) {
    constexpr int N_IN = (ZC / 32) * (D / 64), N_BR = 4 * (BW / 64) * (D / 32), N_OUT = (D / 64) * (D / 32), N_UP = NEX * 2 * (D / 64) * (ED / 32), N_DN = NEX * (ED / 64) * (D / 32);
    constexpr int NITEMS = (PART == 0) ? (N_IN + N_BR + N_OUT) : (N_UP + N_DN);
    LAS float* scr = (LAS float*)(lds + wave * 16384);
    const int NIT = hi < NITEMS ? hi : NITEMS;
    if (lo + gw >= NIT) return;
    TrItem cur = tr_decode<PART>(p, l, lo + gw); v4f va[8], vb[8];
    tr_load(cur, lane, va);
    for (int it = lo + gw; it < NIT; it += 2 * NGW) {
        const int i1 = it + NGW, i2 = it + 2 * NGW; TrItem nx = cur;
        if (i1 < NIT) { nx = tr_decode<PART>(p, l, i1); } tr_load(nx, lane, vb);
        tr_store(cur, va, scr, lane, nostore);
        if (i1 >= NIT) break;
        cur = nx; if (i2 < NIT) { cur = tr_decode<PART>(p, l, i2); } tr_load(cur, lane, va);
        tr_store(nx, vb, scr, lane, nostore);
        if (i2 >= NIT) break;
    }
}
__device__ __forceinline__ void phase_xprep(const Params& p, int l, const void* xin, bool xbf, LAS unsigned char* lds, int gw, int NGW, int tid, int lane) {
    const float* w_in = p.in[I_WIN] + (size_t)l * D * INC;
    constexpr int XP = 2052; LAS float* xt = (LAS float*)lds; LAS float* part = (LAS float*)lds;
    const int wave = tid >> 6, n_l = lane & 15, kq = lane >> 4, wg = gw >> 3, G = NGW >> 3;
    const int colw = n_l < 8 ? 4608 + n_l : 6152 + (n_l - 8);
    float bw[64];
#pragma unroll
    for (int q = 0; q < 64; ++q) bw[q] = w_in[(size_t)(256 * wave + 16 * (q >> 2) + 4 * kq + (q & 3)) * INC + colw];
    unsigned char* XB = p.ws + WS_XB; float* SMALL = (float*)(p.ws + WS_SMALL);
    __syncthreads();
    for (int tg = wg; tg < T / 16; tg += G) {
        {   v4f va[8], vb[8]; const size_t m0 = (size_t)tg * 16 + 2 * wave;
#pragma unroll
            for (int j = 0; j < 8; ++j) { va[j] = ld4(xin, m0 * D + 4 * lane + 256 * j, xbf); vb[j] = ld4(xin, (m0 + 1) * D + 4 * lane + 256 * j, xbf); }
#pragma unroll
            for (int rr = 0; rr < 2; ++rr) { unsigned* xo = (unsigned*)(XB + (m0 + rr) * D) + lane;
#pragma unroll
                for (int j = 0; j < 8; ++j) { const v4f v = rr ? vb[j] : va[j]; unsigned w = 0; w = __builtin_amdgcn_cvt_pk_fp8_f32(v.x, v.y, w, false); w = __builtin_amdgcn_cvt_pk_fp8_f32(v.z, v.w, w, true); xo[64 * j] = w;
                    *(LAS v4f*)(xt + (2 * wave + rr) * XP + 4 * lane + 256 * j) = v; } } }
        __syncthreads();
        {   pg8::f32x4 acc[4];
#pragma unroll
            for (int i = 0; i < 4; ++i) acc[i] = (pg8::f32x4){0.f, 0.f, 0.f, 0.f};
            const LAS float* xa = xt + n_l * XP + 256 * wave + 4 * kq;
#pragma unroll
            for (int s2 = 0; s2 < 16; ++s2) { const v4f a4 = *(const LAS v4f*)(xa + 16 * s2);
                acc[0] = __builtin_amdgcn_mfma_f32_16x16x4f32(a4.x, bw[4 * s2 + 0], acc[0], 0, 0, 0); acc[1] = __builtin_amdgcn_mfma_f32_16x16x4f32(a4.y, bw[4 * s2 + 1], acc[1], 0, 0, 0);
                acc[2] = __builtin_amdgcn_mfma_f32_16x16x4f32(a4.z, bw[4 * s2 + 2], acc[2], 0, 0, 0); acc[3] = __builtin_amdgcn_mfma_f32_16x16x4f32(a4.w, bw[4 * s2 + 3], acc[3], 0, 0, 0); }
            const pg8::f32x4 tot = (acc[0] + acc[1]) + (acc[2] + acc[3]);
            __syncthreads();
#pragma unroll
            for (int j = 0; j < 4; ++j) part[(wave * 16 + 4 * kq + j) * 16 + n_l] = tot[j]; }
        __syncthreads();
        if (tid < 256) { float a = 0.f;
#pragma unroll
            for (int w = 0; w < 8; ++w) a += part[w * 256 + tid];
            SMALL[(size_t)tg * 256 + tid] = a; }
        __syncthreads();
    }
}


typedef short bf16x8_t __attribute__((ext_vector_type(8)));
__device__ __forceinline__ void ml_pre_item(const Params& p, int l, LAS unsigned char* lds, int item, int tid, int wave, int lane) {
    const int h = item & 3, n = item >> 2; const size_t t0 = (size_t)n * 64;
    const bf16* Z = (const bf16*)(p.ws + WS_Z); const float* SMALL = (const float*)(p.ws + WS_SMALL);
    bf16* MQ = (bf16*)(p.ws + WS_MQ) + (size_t)item * 4096; bf16* MS = (bf16*)(p.ws + WS_MS) + (size_t)item * 4096; bf16* MK = (bf16*)(p.ws + WS_MK) + (size_t)item * 4096;
    bf16* MV = (bf16*)(p.ws + WS_MV) + (size_t)item * 9216; float* MFL = (float*)(p.ws + WS_MFL);
    LAS float* qs = (LAS float*)lds;
    LAS float* ks = qs + 64 * 65;
    LAS float* bs = ks + 64 * 65;
    LAS unsigned short* vs = (LAS unsigned short*)(bs + 128);
    { const int tk = tid >> 3, c8 = tid & 7; float f[8];
      unpack8(*(const v4u*)(Z + (t0 + tk) * ZC + ZC_MLQ + h * 64 + 8 * c8), f);
#pragma unroll
      for (int i = 0; i < 8; ++i) qs[tk * 65 + 8 * c8 + i] = f[i];
      unpack8(*(const v4u*)(Z + (t0 + tk) * ZC + ZC_MLK + h * 64 + 8 * c8), f);
#pragma unroll
      for (int i = 0; i < 8; ++i) ks[tk * 65 + 8 * c8 + i] = f[i]; }
#pragma unroll
    for (int r = 0; r < 2; ++r) { const int idx = tid + 512 * r, tk = idx >> 4, c8 = idx & 15;
        *(LAS v4u*)(vs + tk * 136 + 8 * c8) = *(const v4u*)(Z + (t0 + tk) * ZC + ZC_MLV + h * 128 + 8 * c8); }
    if (wave == 0) { const float fp = SMALL[(t0 + lane) * 16 + 12 + h] + p.in[I_MLFB][l * 4 + h]; const float lf = -softplusf_(-fp);
        bs[lane] = wave_scan_incl(lf); bs[64 + lane] = SMALL[(t0 + lane) * 16 + 8 + h] + p.in[I_MLIB][l * 4 + h]; }
    __syncthreads();
    const float blast = bs[63];
    { const int i = tid >> 3, jb = tid & 7; const float bi = bs[i];
      { const float e = __expf(bi) * 0.125f; float o[8];
#pragma unroll
        for (int x = 0; x < 8; ++x) o[x] = qs[i * 65 + 8 * jb + x] * e;
        v4u w; w.x = pk2(o[0], o[1]); w.y = pk2(o[2], o[3]); w.z = pk2(o[4], o[5]); w.w = pk2(o[6], o[7]); *(v4u*)(MQ + i * 64 + 8 * jb) = w; }
      {
          const int ti = wave >> 1, c16 = lane & 15, g4 = lane >> 4, i2 = 16 * ti + c16; const float bi2 = bs[i2];
#define ML_F8(dst, base) do { const LAS float* _b = (base); const v4u _w = (v4u){pg8::cvt_pk_bf16(_b[0], _b[1]), pg8::cvt_pk_bf16(_b[2], _b[3]), pg8::cvt_pk_bf16(_b[4], _b[5]), pg8::cvt_pk_bf16(_b[6], _b[7])}; dst = __builtin_bit_cast(bf16x8_t, _w); } while (0)
          bf16x8_t bq[2];
#pragma unroll
          for (int s2 = 0; s2 < 2; ++s2) ML_F8(bq[s2], qs + i2 * 65 + 32 * s2 + 8 * g4);
#pragma unroll
          for (int jj = 0; jj < 2; ++jj) { const int tj = 2 * (wave & 1) + jj; v2u sw = (v2u){0u, 0u};
              if (tj <= ti) { pg8::f32x4 d = {0.f, 0.f, 0.f, 0.f};
#pragma unroll
                  for (int s2 = 0; s2 < 2; ++s2) { bf16x8_t a; ML_F8(a, ks + (16 * tj + c16) * 65 + 32 * s2 + 8 * g4); d = __builtin_amdgcn_mfma_f32_16x16x32_bf16(a, bq[s2], d, 0, 0, 0); }
                  float v4[4];
#pragma unroll
                  for (int r = 0; r < 4; ++r) { const int j = 16 * tj + 4 * g4 + r; v4[r] = (j <= i2) ? __expf(bi2 - bs[j] + bs[64 + j]) * d[r] * 0.125f : 0.f; }
                  sw = (v2u){pk2(v4[0], v4[1]), pk2(v4[2], v4[3])}; }
              *(v2u*)(MS + i2 * 64 + 16 * tj + 4 * g4) = sw; }
#undef ML_F8
      }
      { float o[8];
#pragma unroll
        for (int x = 0; x < 8; ++x) { const int j = 8 * jb + x; o[x] = ks[j * 65 + i] * __expf(blast - bs[j] + bs[64 + j]); }
        v4u w; w.x = pk2(o[0], o[1]); w.y = pk2(o[2], o[3]); w.z = pk2(o[4], o[5]); w.w = pk2(o[6], o[7]); *(v4u*)(MK + i * 64 + 8 * jb) = w; }
    }
    { const int c = tid >> 2, jq = tid & 3; unsigned w[8];
#pragma unroll
      for (int x = 0; x < 8; ++x) w[x] = (unsigned)vs[(16 * jq + 2 * x) * 136 + c] | ((unsigned)vs[(16 * jq + 2 * x + 1) * 136 + c] << 16);
      *(v4u*)(MV + c * 64 + 16 * jq) = (v4u){w[0], w[1], w[2], w[3]}; *(v4u*)(MV + c * 64 + 16 * jq + 8) = (v4u){w[4], w[5], w[6], w[7]};
      if (tid < 64) { const int c2 = 128 + (tid >> 2); const unsigned one = (c2 == 128) ? 0x3F803F80u : 0u;
          *(v4u*)(MV + c2 * 64 + 16 * jq) = (v4u){one, one, one, one}; *(v4u*)(MV + c2 * 64 + 16 * jq + 8) = (v4u){one, one, one, one}; } }
    if (tid == 0) MFL[item] = __expf(blast);
    __syncthreads();
}
struct MlFrags { bf16x8_t q[2], s[2], kt[2], vt[2]; float fl; };
__device__ __forceinline__ void ml_load(MlFrags& F, const Params& p, int item, int offA, int offV) {
    const bf16* MQ = (const bf16*)(p.ws + WS_MQ) + (size_t)item * 4096; const bf16* MS = (const bf16*)(p.ws + WS_MS) + (size_t)item * 4096; const bf16* MK = (const bf16*)(p.ws + WS_MK) + (size_t)item * 4096;
    const bf16* MV = (const bf16*)(p.ws + WS_MV) + (size_t)item * 9216;
#pragma unroll
    for (int ks = 0; ks < 2; ++ks) { F.q[ks] = *(const bf16x8_t*)(MQ + offA + 32 * ks); F.s[ks] = *(const bf16x8_t*)(MS + offA + 32 * ks); F.kt[ks] = *(const bf16x8_t*)(MK + offA + 32 * ks); F.vt[ks] = *(const bf16x8_t*)(MV + offV + 32 * ks); }
    F.fl = ((const float*)(p.ws + WS_MFL))[item];
}
__device__ __forceinline__ void ml_seq(const Params& p, LAS unsigned char* lds, int wgi, int wave, int lane) {
    const int u = wgi * 2 + (wave >> 2), wi = wave & 3, h = u / 9, sl = u % 9, g = lane >> 4, c = lane & 15;
    LAS unsigned short* CT = (LAS unsigned short*)(lds + (wave >> 2) * 4096);
    float* HO = (float*)(p.ws + WS_HO); float* HDEN = (float*)(p.ws + WS_HDEN);
    const int offA = (16 * wi + c) * 64 + 8 * g, offV = (16 * sl + c) * 64 + 8 * g;
    *(LAS v2u*)(CT + c * 64 + 16 * wi + 4 * g) = (v2u){0u, 0u};
    pg8::f32x4 Cacc = {0.f, 0.f, 0.f, 0.f};
    __syncthreads();
    MlFrags F0, F1;
    ml_load(F0, p, h, offA, offV);
#define ML_STEP(F, n_) do { const int cur = (n_) & 1; \
        const bf16x8_t c0 = *(const LAS bf16x8_t*)(CT + cur * 1024 + c * 64 + 8 * g), c1 = *(const LAS bf16x8_t*)(CT + cur * 1024 + c * 64 + 32 + 8 * g); \
        pg8::f32x4 num = {0.f, 0.f, 0.f, 0.f}; \
        num = __builtin_amdgcn_mfma_f32_16x16x32_bf16(F.q[0], c0, num, 0, 0, 0); num = __builtin_amdgcn_mfma_f32_16x16x32_bf16(F.q[1], c1, num, 0, 0, 0); \
        num = __builtin_amdgcn_mfma_f32_16x16x32_bf16(F.s[0], F.vt[0], num, 0, 0, 0); num = __builtin_amdgcn_mfma_f32_16x16x32_bf16(F.s[1], F.vt[1], num, 0, 0, 0); \
        Cacc = Cacc * F.fl; \
        Cacc = __builtin_amdgcn_mfma_f32_16x16x32_bf16(F.kt[0], F.vt[0], Cacc, 0, 0, 0); Cacc = __builtin_amdgcn_mfma_f32_16x16x32_bf16(F.kt[1], F.vt[1], Cacc, 0, 0, 0); \
        { v2u w; w.x = pk2(Cacc[0], Cacc[1]); w.y = pk2(Cacc[2], Cacc[3]); *(LAS v2u*)(CT + (cur ^ 1) * 1024 + c * 64 + 16 * wi + 4 * g) = w; } \
        { const size_t tb = (size_t)(n_) * 64 + 16 * wi + 4 * g; \
          if (sl < 8) { _Pragma("unroll") for (int r = 0; r < 4; ++r) HO[(tb + r) * BW + h * 128 + 16 * sl + c] = num[r]; } \
          else if (c == 0) { _Pragma("unroll") for (int r = 0; r < 4; ++r) HDEN[(tb + r) * 4 + h] = num[r]; } } \
        LDS_BAR(); } while (0)
    for (int n = 0; n < T / 64; n += 2) {
        ml_load(F1, p, (n + 1) * 4 + h, offA, offV);
        ML_STEP(F0, n);
        ml_load(F0, p, ((n + 2 < T / 64) ? n + 2 : n) * 4 + h, offA, offV);
        ML_STEP(F1, n + 1);
    }
#undef ML_STEP
}


constexpr int QP = 132;
__device__ __forceinline__ void gdn_pre_item(const Params& p, int l, LAS unsigned char* lds, int item, int tid, int wave, int lane) {
    const int h = item & 3, n = item >> 2; const size_t t0 = (size_t)n * 64;
    const bf16* Z = (const bf16*)(p.ws + WS_Z); const float* SMALL = (const float*)(p.ws + WS_SMALL);
    float* GU = (float*)(p.ws + WS_GU) + (size_t)item * 8192; bf16* GNW = (bf16*)(p.ws + WS_GNW) + (size_t)item * 8192; bf16* GQG = (bf16*)(p.ws + WS_GQG) + (size_t)item * 8192;
    bf16* GAT = (bf16*)(p.ws + WS_GAT) + (size_t)item * 4096; bf16* GKT = (bf16*)(p.ws + WS_GKT) + (size_t)item * 8192; float* GDL = (float*)(p.ws + WS_GDL);
    const float* cw = p.in[I_CONVW] + (size_t)l * 4 * 1536;
    LAS float* qs = (LAS float*)lds; LAS float* ks = qs + 64 * QP; LAS float* vs = ks + 64 * QP; LAS float* Ls = vs + 64 * QP;   LAS float* gcs = Ls + 64 * 68; LAS float* bts = gcs + 64; LAS float* btg = bts + 64;
    LAS unsigned short* zq = (LAS unsigned short*)(lds + 131584); LAS unsigned short* zk = (LAS unsigned short*)Ls; LAS unsigned short* zv = (LAS unsigned short*)vs; LAS float* cwl = btg + 64;
    float gate_b = 0.f, gate_a = 0.f; if (wave == 0) { gate_b = SMALL[(t0 + lane) * 16 + h]; gate_a = SMALL[(t0 + lane) * 16 + 4 + h]; }
    {   v4u zr[7]; v4f wr4 = (v4f){0.f, 0.f, 0.f, 0.f};
#pragma unroll
        for (int q = 0; q < 7; ++q) { const int idx = tid + 512 * q; zr[q] = (v4u){0u, 0u, 0u, 0u};
            if (idx < 3216) { const int seg = idx / 1072, rem = idx % 1072, r = rem >> 4, c16 = rem & 15; const long tt = (long)t0 - 3 + r;
                if (tt >= 0) zr[q] = *(const v4u*)(Z + (size_t)tt * ZC + ZC_GDN + seg * 512 + h * 128 + 8 * c16); } }
        if (tid < 384) { const int j = tid / 96, rest = tid % 96, i = rest >> 5, c4 = rest & 31; wr4 = *(const v4f*)(cw + j * 1536 + i * 512 + h * 128 + 4 * c4); }
#pragma unroll
        for (int q = 0; q < 7; ++q) { const int idx = tid + 512 * q;
            if (idx < 3216) { const int seg = idx / 1072, rem = idx % 1072; LAS unsigned short* zb = seg == 0 ? zq : (seg == 1 ? zk : zv); *(LAS v4u*)(zb + 8 * rem) = zr[q]; } }
        if (tid < 384) *(LAS v4f*)(cwl + 4 * tid) = wr4;
    }
    __syncthreads();
    { const int tk = tid >> 3, part = tid & 7; float av[16];
#pragma unroll 1
      for (int i = 0; i < 3; ++i) { float a[16]; const LAS unsigned short* zb = i == 0 ? zq : (i == 1 ? zk : zv);
#pragma unroll
        for (int x = 0; x < 16; ++x) a[x] = 0.f;
#pragma unroll
        for (int j = 0; j < 4; ++j) { const LAS unsigned short* src = zb + (tk + j) * 128 + 16 * part; float x0[8], x1[8]; unpack8(*(const LAS v4u*)src, x0); unpack8(*(const LAS v4u*)(src + 8), x1);
            const LAS float* wp = cwl + (j * 3 + i) * 128 + 16 * part;
#pragma unroll
            for (int x4 = 0; x4 < 2; ++x4) { const v4f w0 = *(const LAS v4f*)(wp + 4 * x4), w1 = *(const LAS v4f*)(wp + 8 + 4 * x4);
                a[4 * x4] += w0.x * x0[4 * x4]; a[4 * x4 + 1] += w0.y * x0[4 * x4 + 1]; a[4 * x4 + 2] += w0.z * x0[4 * x4 + 2]; a[4 * x4 + 3] += w0.w * x0[4 * x4 + 3];
                a[8 + 4 * x4] += w1.x * x1[4 * x4]; a[8 + 4 * x4 + 1] += w1.y * x1[4 * x4 + 1]; a[8 + 4 * x4 + 2] += w1.z * x1[4 * x4 + 2]; a[8 + 4 * x4 + 3] += w1.w * x1[4 * x4 + 3]; } }
        float ss = 0.f;
#pragma unroll
        for (int x = 0; x < 16; ++x) { a[x] = siluf_(a[x]); ss += a[x] * a[x]; }
        if (i < 2) { ss = sum8(ss); const float r = rsqrtf(ss + 1e-6f) * (i == 0 ? 0.08838834764831845f : 1.f);
#pragma unroll
            for (int x = 0; x < 16; ++x) a[x] *= r;
            LAS float* dst = (i == 0 ? qs : ks) + tk * QP + 16 * part;
#pragma unroll
            for (int x4 = 0; x4 < 4; ++x4) *(LAS v4f*)(dst + 4 * x4) = (v4f){a[4 * x4], a[4 * x4 + 1], a[4 * x4 + 2], a[4 * x4 + 3]}; }
        else {
#pragma unroll
            for (int x = 0; x < 16; ++x) av[x] = a[x]; } }
      __syncthreads();
      { LAS float* dst = vs + tk * QP + 16 * part;
#pragma unroll
        for (int x4 = 0; x4 < 4; ++x4) *(LAS v4f*)(dst + 4 * x4) = (v4f){av[4 * x4], av[4 * x4 + 1], av[4 * x4 + 2], av[4 * x4 + 3]}; } }
    if (wave == 0) { const float bb = gate_b, aa = gate_a;
        const float g = -__expf(p.in[I_ALOG][l * 4 + h]) * softplusf_(aa + p.in[I_DTB][l * 4 + h]);
        const float gc = wave_scan_incl(g), bt = sigmoidf_(bb); gcs[lane] = gc; bts[lane] = bt; btg[lane] = bt * __expf(gc); }
    __syncthreads();
    { const int ti = wave >> 1, c16 = lane & 15, g4 = lane >> 4, i = 16 * ti + c16; const float gi = gcs[i], bi = bts[i];
#define GDN_F8(dst, base) do { const v4f _a = *(const LAS v4f*)(base), _b = *(const LAS v4f*)((base) + 4); const v4u _w = (v4u){pg8::cvt_pk_bf16(_a.x, _a.y), pg8::cvt_pk_bf16(_a.z, _a.w), pg8::cvt_pk_bf16(_b.x, _b.y), pg8::cvt_pk_bf16(_b.z, _b.w)}; dst = __builtin_bit_cast(bf16x8_t, _w); } while (0)
      bf16x8_t bk[4], bq[4];
#pragma unroll
      for (int s4 = 0; s4 < 4; ++s4) { GDN_F8(bk[s4], ks + i * QP + 32 * s4 + 8 * g4); GDN_F8(bq[s4], qs + i * QP + 32 * s4 + 8 * g4); }
#pragma unroll
      for (int jj = 0; jj < 2; ++jj) { const int tj = 2 * (wave & 1) + jj; v4f lv = (v4f){0.f, 0.f, 0.f, 0.f}; v2u aw = (v2u){0u, 0u};
          if (tj <= ti) { pg8::f32x4 dk = {0.f, 0.f, 0.f, 0.f}, dq = {0.f, 0.f, 0.f, 0.f};
#pragma unroll
              for (int s4 = 0; s4 < 4; ++s4) { bf16x8_t a; GDN_F8(a, ks + (16 * tj + c16) * QP + 32 * s4 + 8 * g4);
                  dk = __builtin_amdgcn_mfma_f32_16x16x32_bf16(a, bk[s4], dk, 0, 0, 0); dq = __builtin_amdgcn_mfma_f32_16x16x32_bf16(a, bq[s4], dq, 0, 0, 0); }
              float l4[4], a4[4];
#pragma unroll
              for (int r = 0; r < 4; ++r) { const int j = 16 * tj + 4 * g4 + r; const float dc = __expf(gi - gcs[j]); l4[r] = (j < i) ? bi * dk[r] * dc : 0.f; a4[r] = (j <= i) ? dq[r] * dc : 0.f; }
              lv = (v4f){l4[0], l4[1], l4[2], l4[3]}; aw = (v2u){pk2(a4[0], a4[1]), pk2(a4[2], a4[3])}; }
          *(LAS v4f*)(Ls + i * 68 + 16 * tj + 4 * g4) = lv; *(v2u*)(GAT + i * 64 + 16 * tj + 4 * g4) = aw; }
#undef GDN_F8
    }
    __syncthreads();
    if (tid < 256) {
        const int c = tid; int vz; asm volatile("v_mov_b32 %0, 0" : "=v"(vz));
        const LAS float* rp = (c < 128) ? (vs + c) : (ks + (c - 128)); const LAS float* mp = ((c < 128) ? bts : btg) + vz;
#define GDN_RHS(i) (rp[(i) * QP] * mp[(i)])
#define GDN_L4(i, j4) (*(const LAS v4f*)(Ls + (i) * 68 + 4 * (j4) + vz))
        float x0 = GDN_RHS(0); __builtin_amdgcn_sched_barrier(0);
        float x1 = GDN_RHS(1); { const v4f l0 = GDN_L4(1, 0); __builtin_amdgcn_sched_barrier(0); x1 -= l0.x * x0; } __builtin_amdgcn_sched_barrier(0);
        float x2 = GDN_RHS(2); { const v4f l0 = GDN_L4(2, 0); __builtin_amdgcn_sched_barrier(0); x2 -= l0.x * x0; x2 -= l0.y * x1; } __builtin_amdgcn_sched_barrier(0);
        float x3 = GDN_RHS(3); { const v4f l0 = GDN_L4(3, 0); __builtin_amdgcn_sched_barrier(0); x3 -= l0.x * x0; x3 -= l0.y * x1; x3 -= l0.z * x2; } __builtin_amdgcn_sched_barrier(0);
        float x4 = GDN_RHS(4); { const v4f l0 = GDN_L4(4, 0); __builtin_amdgcn_sched_barrier(0); x4 -= l0.x * x0; x4 -= l0.y * x1; x4 -= l0.z * x2; x4 -= l0.w * x3; } __builtin_amdgcn_sched_barrier(0);
        float x5 = GDN_RHS(5); { const v4f l0 = GDN_L4(5, 0); const v4f l1 = GDN_L4(5, 1); __builtin_amdgcn_sched_barrier(0); x5 -= l0.x * x0; x5 -= l0.y * x1; x5 -= l0.z * x2; x5 -= l0.w * x3; x5 -= l1.x * x4; } __builtin_amdgcn_sched_barrier(0);
        float x6 = GDN_RHS(6); { const v4f l0 = GDN_L4(6, 0); const v4f l1 = GDN_L4(6, 1); __builtin_amdgcn_sched_barrier(0); x6 -= l0.x * x0; x6 -= l0.y * x1; x6 -= l0.z * x2; x6 -= l0.w * x3; x6 -= l1.x * x4; x6 -= l1.y * x5; } __builtin_amdgcn_sched_barrier(0);
        float x7 = GDN_RHS(7); { const v4f l0 = GDN_L4(7, 0); const v4f l1 = GDN_L4(7, 1); __builtin_amdgcn_sched_barrier(0); x7 -= l0.x * x0; x7 -= l0.y * x1; x7 -= l0.z * x2; x7 -= l0.w * x3; x7 -= l1.x * x4; x7 -= l1.y * x5; x7 -= l1.z * x6; } __builtin_amdgcn_sched_barrier(0);
        float x8 = GDN_RHS(8); { const v4f l0 = GDN_L4(8, 0); const v4f l1 = GDN_L4(8, 1); __builtin_amdgcn_sched_barrier(0); x8 -= l0.x * x0; x8 -= l0.y * x1; x8 -= l0.z * x2; x8 -= l0.w * x3; x8 -= l1.x * x4; x8 -= l1.y * x5; x8 -= l1.z * x6; x8 -= l1.w * x7; } __builtin_amdgcn_sched_barrier(0);
        float x9 = GDN_RHS(9); { const v4f l0 = GDN_L4(9, 0); const v4f l1 = GDN_L4(9, 1); const v4f l2 = GDN_L4(9, 2); __builtin_amdgcn_sched_barrier(0); x9 -= l0.x * x0; x9 -= l0.y * x1; x9 -= l0.z * x2; x9 -= l0.w * x3; x9 -= l1.x * x4; x9 -= l1.y * x5; x9 -= l1.z * x6; x9 -= l1.w * x7; x9 -= l2.x * x8; } __builtin_amdgcn_sched_barrier(0);
        float x10 = GDN_RHS(10); { const v4f l0 = GDN_L4(10, 0); const v4f l1 = GDN_L4(10, 1); const v4f l2 = GDN_L4(10, 2); __builtin_amdgcn_sched_barrier(0); x10 -= l0.x * x0; x10 -= l0.y * x1; x10 -= l0.z * x2; x10 -= l0.w * x3; x10 -= l1.x * x4; x10 -= l1.y * x5; x10 -= l1.z * x6; x10 -= l1.w * x7; x10 -= l2.x * x8; x10 -= l2.y * x9; } __builtin_amdgcn_sched_barrier(0);
        float x11 = GDN_RHS(11); { const v4f l0 = GDN_L4(11, 0); const v4f l1 = GDN_L4(11, 1); const v4f l2 = GDN_L4(11, 2); __builtin_amdgcn_sched_barrier(0); x11 -= l0.x * x0; x11 -= l0.y * x1; x11 -= l0.z * x2; x11 -= l0.w * x3; x11 -= l1.x * x4; x11 -= l1.y * x5; x11 -= l1.z * x6; x11 -= l1.w * x7; x11 -= l2.x * x8; x11 -= l2.y * x9; x11 -= l2.z * x10; } __builtin_amdgcn_sched_barrier(0);
        float x12 = GDN_RHS(12); { const v4f l0 = GDN_L4(12, 0); const v4f l1 = GDN_L4(12, 1); const v4f l2 = GDN_L4(12, 2); __builtin_amdgcn_sched_barrier(0); x12 -= l0.x * x0; x12 -= l0.y * x1; x12 -= l0.z * x2; x12 -= l0.w * x3; x12 -= l1.x * x4; x12 -= l1.y * x5; x12 -= l1.z * x6; x12 -= l1.w * x7; x12 -= l2.x * x8; x12 -= l2.y * x9; x12 -= l2.z * x10; x12 -= l2.w * x11; } __builtin_amdgcn_sched_barrier(0);
        float x13 = GDN_RHS(13); { const v4f l0 = GDN_L4(13, 0); const v4f l1 = GDN_L4(13, 1); const v4f l2 = GDN_L4(13, 2); const v4f l3 = GDN_L4(13, 3); __builtin_amdgcn_sched_barrier(0); x13 -= l0.x * x0; x13 -= l0.y * x1; x13 -= l0.z * x2; x13 -= l0.w * x3; x13 -= l1.x * x4; x13 -= l1.y * x5; x13 -= l1.z * x6; x13 -= l1.w * x7; x13 -= l2.x * x8; x13 -= l2.y * x9; x13 -= l2.z * x10; x13 -= l2.w * x11; x13 -= l3.x * x12; } __builtin_amdgcn_sched_barrier(0);
        float x14 = GDN_RHS(14); { const v4f l0 = GDN_L4(14, 0); const v4f l1 = GDN_L4(14, 1); const v4f l2 = GDN_L4(14, 2); const v4f l3 = GDN_L4(14, 3); __builtin_amdgcn_sched_barrier(0); x14 -= l0.x * x0; x14 -= l0.y * x1; x14 -= l0.z * x2; x14 -= l0.w * x3; x14 -= l1.x * x4; x14 -= l1.y * x5; x14 -= l1.z * x6; x14 -= l1.w * x7; x14 -= l2.x * x8; x14 -= l2.y * x9; x14 -= l2.z * x10; x14 -= l2.w * x11; x14 -= l3.x * x12; x14 -= l3.y * x13; } __builtin_amdgcn_sched_barrier(0);
        float x15 = GDN_RHS(15); { const v4f l0 = GDN_L4(15, 0); const v4f l1 = GDN_L4(15, 1); const v4f l2 = GDN_L4(15, 2); const v4f l3 = GDN_L4(15, 3); __builtin_amdgcn_sched_barrier(0); x15 -= l0.x * x0; x15 -= l0.y * x1; x15 -= l0.z * x2; x15 -= l0.w * x3; x15 -= l1.x * x4; x15 -= l1.y * x5; x15 -= l1.z * x6; x15 -= l1.w * x7; x15 -= l2.x * x8; x15 -= l2.y * x9; x15 -= l2.z * x10; x15 -= l2.w * x11; x15 -= l3.x * x12; x15 -= l3.y * x13; x15 -= l3.z * x14; } __builtin_amdgcn_sched_barrier(0);
        float x16 = GDN_RHS(16); { const v4f l0 = GDN_L4(16, 0); const v4f l1 = GDN_L4(16, 1); const v4f l2 = GDN_L4(16, 2); const v4f l3 = GDN_L4(16, 3); __builtin_amdgcn_sched_barrier(0); x16 -= l0.x * x0; x16 -= l0.y * x1; x16 -= l0.z * x2; x16 -= l0.w * x3; x16 -= l1.x * x4; x16 -= l1.y * x5; x16 -= l1.z * x6; x16 -= l1.w * x7; x16 -= l2.x * x8; x16 -= l2.y * x9; x16 -= l2.z * x10; x16 -= l2.w * x11; x16 -= l3.x * x12; x16 -= l3.y * x13; x16 -= l3.z * x14; x16 -= l3.w * x15; } __builtin_amdgcn_sched_barrier(0);
        float x17 = GDN_RHS(17); { const v4f l0 = GDN_L4(17, 0); const v4f l1 = GDN_L4(17, 1); const v4f l2 = GDN_L4(17, 2); const v4f l3 = GDN_L4(17, 3); const v4f l4 = GDN_L4(17, 4); __builtin_amdgcn_sched_barrier(0); x17 -= l0.x * x0; x17 -= l0.y * x1; x17 -= l0.z * x2; x17 -= l0.w * x3; x17 -= l1.x * x4; x17 -= l1.y * x5; x17 -= l1.z * x6; x17 -= l1.w * x7; x17 -= l2.x * x8; x17 -= l2.y * x9; x17 -= l2.z * x10; x17 -= l2.w * x11; x17 -= l3.x * x12; x17 -= l3.y * x13; x17 -= l3.z * x14; x17 -= l3.w * x15; x17 -= l4.x * x16; } __builtin_amdgcn_sched_barrier(0);
        float x18 = GDN_RHS(18); { const v4f l0 = GDN_L4(18, 0); const v4f l1 = GDN_L4(18, 1); const v4f l2 = GDN_L4(18, 2); const v4f l3 = GDN_L4(18, 3); const v4f l4 = GDN_L4(18, 4); __builtin_amdgcn_sched_barrier(0); x18 -= l0.x * x0; x18 -= l0.y * x1; x18 -= l0.z * x2; x18 -= l0.w * x3; x18 -= l1.x * x4; x18 -= l1.y * x5; x18 -= l1.z * x6; x18 -= l1.w * x7; x18 -= l2.x * x8; x18 -= l2.y * x9; x18 -= l2.z * x10; x18 -= l2.w * x11; x18 -= l3.x * x12; x18 -= l3.y * x13; x18 -= l3.z * x14; x18 -= l3.w * x15; x18 -= l4.x * x16; x18 -= l4.y * x17; } __builtin_amdgcn_sched_barrier(0);
        float x19 = GDN_RHS(19); { const v4f l0 = GDN_L4(19, 0); const v4f l1 = GDN_L4(19, 1); const v4f l2 = GDN_L4(19, 2); const v4f l3 = GDN_L4(19, 3); const v4f l4 = GDN_L4(19, 4); __builtin_amdgcn_sched_barrier(0); x19 -= l0.x * x0; x19 -= l0.y * x1; x19 -= l0.z * x2; x19 -= l0.w * x3; x19 -= l1.x * x4; x19 -= l1.y * x5; x19 -= l1.z * x6; x19 -= l1.w * x7; x19 -= l2.x * x8; x19 -= l2.y * x9; x19 -= l2.z * x10; x19 -= l2.w * x11; x19 -= l3.x * x12; x19 -= l3.y * x13; x19 -= l3.z * x14; x19 -= l3.w * x15; x19 -= l4.x * x16; x19 -= l4.y * x17; x19 -= l4.z * x18; } __builtin_amdgcn_sched_barrier(0);
        float x20 = GDN_RHS(20); { const v4f l0 = GDN_L4(20, 0); const v4f l1 = GDN_L4(20, 1); const v4f l2 = GDN_L4(20, 2); const v4f l3 = GDN_L4(20, 3); const v4f l4 = GDN_L4(20, 4); __builtin_amdgcn_sched_barrier(0); x20 -= l0.x * x0; x20 -= l0.y * x1; x20 -= l0.z * x2; x20 -= l0.w * x3; x20 -= l1.x * x4; x20 -= l1.y * x5; x20 -= l1.z * x6; x20 -= l1.w * x7; x20 -= l2.x * x8; x20 -= l2.y * x9; x20 -= l2.z * x10; x20 -= l2.w * x11; x20 -= l3.x * x12; x20 -= l3.y * x13; x20 -= l3.z * x14; x20 -= l3.w * x15; x20 -= l4.x * x16; x20 -= l4.y * x17; x20 -= l4.z * x18; x20 -= l4.w * x19; } __builtin_amdgcn_sched_barrier(0);
        float x21 = GDN_RHS(21); { const v4f l0 = GDN_L4(21, 0); const v4f l1 = GDN_L4(21, 1); const v4f l2 = GDN_L4(21, 2); const v4f l3 = GDN_L4(21, 3); const v4f l4 = GDN_L4(21, 4); const v4f l5 = GDN_L4(21, 5); __builtin_amdgcn_sched_barrier(0); x21 -= l0.x * x0; x21 -= l0.y * x1; x21 -= l0.z * x2; x21 -= l0.w * x3; x21 -= l1.x * x4; x21 -= l1.y * x5; x21 -= l1.z * x6; x21 -= l1.w * x7; x21 -= l2.x * x8; x21 -= l2.y * x9; x21 -= l2.z * x10; x21 -= l2.w * x11; x21 -= l3.x * x12; x21 -= l3.y * x13; x21 -= l3.z * x14; x21 -= l3.w * x15; x21 -= l4.x * x16; x21 -= l4.y * x17; x21 -= l4.z * x18; x21 -= l4.w * x19; x21 -= l5.x * x20; } __builtin_amdgcn_sched_barrier(0);
        float x22 = GDN_RHS(22); { const v4f l0 = GDN_L4(22, 0); const v4f l1 = GDN_L4(22, 1); const v4f l2 = GDN_L4(22, 2); const v4f l3 = GDN_L4(22, 3); const v4f l4 = GDN_L4(22, 4); const v4f l5 = GDN_L4(22, 5); __builtin_amdgcn_sched_barrier(0); x22 -= l0.x * x0; x22 -= l0.y * x1; x22 -= l0.z * x2; x22 -= l0.w * x3; x22 -= l1.x * x4; x22 -= l1.y * x5; x22 -= l1.z * x6; x22 -= l1.w * x7; x22 -= l2.x * x8; x22 -= l2.y * x9; x22 -= l2.z * x10; x22 -= l2.w * x11; x22 -= l3.x * x12; x22 -= l3.y * x13; x22 -= l3.z * x14; x22 -= l3.w * x15; x22 -= l4.x * x16; x22 -= l4.y * x17; x22 -= l4.z * x18; x22 -= l4.w * x19; x22 -= l5.x * x20; x22 -= l5.y * x21; } __builtin_amdgcn_sched_barrier(0);
        float x23 = GDN_RHS(23); { const v4f l0 = GDN_L4(23, 0); const v4f l1 = GDN_L4(23, 1); const v4f l2 = GDN_L4(23, 2); const v4f l3 = GDN_L4(23, 3); const v4f l4 = GDN_L4(23, 4); const v4f l5 = GDN_L4(23, 5); __builtin_amdgcn_sched_barrier(0); x23 -= l0.x * x0; x23 -= l0.y * x1; x23 -= l0.z * x2; x23 -= l0.w * x3; x23 -= l1.x * x4; x23 -= l1.y * x5; x23 -= l1.z * x6; x23 -= l1.w * x7; x23 -= l2.x * x8; x23 -= l2.y * x9; x23 -= l2.z * x10; x23 -= l2.w * x11; x23 -= l3.x * x12; x23 -= l3.y * x13; x23 -= l3.z * x14; x23 -= l3.w * x15; x23 -= l4.x * x16; x23 -= l4.y * x17; x23 -= l4.z * x18; x23 -= l4.w * x19; x23 -= l5.x * x20; x23 -= l5.y * x21; x23 -= l5.z * x22; } __builtin_amdgcn_sched_barrier(0);
        float x24 = GDN_RHS(24); { const v4f l0 = GDN_L4(24, 0); const v4f l1 = GDN_L4(24, 1); const v4f l2 = GDN_L4(24, 2); const v4f l3 = GDN_L4(24, 3); const v4f l4 = GDN_L4(24, 4); const v4f l5 = GDN_L4(24, 5); __builtin_amdgcn_sched_barrier(0); x24 -= l0.x * x0; x24 -= l0.y * x1; x24 -= l0.z * x2; x24 -= l0.w * x3; x24 -= l1.x * x4; x24 -= l1.y * x5; x24 -= l1.z * x6; x24 -= l1.w * x7; x24 -= l2.x * x8; x24 -= l2.y * x9; x24 -= l2.z * x10; x24 -= l2.w * x11; x24 -= l3.x * x12; x24 -= l3.y * x13; x24 -= l3.z * x14; x24 -= l3.w * x15; x24 -= l4.x * x16; x24 -= l4.y * x17; x24 -= l4.z * x18; x24 -= l4.w * x19; x24 -= l5.x * x20; x24 -= l5.y * x21; x24 -= l5.z * x22; x24 -= l5.w * x23; } __builtin_amdgcn_sched_barrier(0);
        float x25 = GDN_RHS(25); { const v4f l0 = GDN_L4(25, 0); const v4f l1 = GDN_L4(25, 1); const v4f l2 = GDN_L4(25, 2); const v4f l3 = GDN_L4(25, 3); const v4f l4 = GDN_L4(25, 4); const v4f l5 = GDN_L4(25, 5); __builtin_amdgcn_sched_barrier(0); x25 -= l0.x * x0; x25 -= l0.y * x1; x25 -= l0.z * x2; x25 -= l0.w * x3; x25 -= l1.x * x4; x25 -= l1.y * x5; x25 -= l1.z * x6; x25 -= l1.w * x7; x25 -= l2.x * x8; x25 -= l2.y * x9; x25 -= l2.z * x10; x25 -= l2.w * x11; x25 -= l3.x * x12; x25 -= l3.y * x13; x25 -= l3.z * x14; x25 -= l3.w * x15; x25 -= l4.x * x16; x25 -= l4.y * x17; x25 -= l4.z * x18; x25 -= l4.w * x19; x25 -= l5.x * x20; x25 -= l5.y * x21; x25 -= l5.z * x22; x25 -= l5.w * x23; } __builtin_amdgcn_sched_barrier(0); { const v4f l6 = GDN_L4(25, 6); __builtin_amdgcn_sched_barrier(0); x25 -= l6.x * x24; } __builtin_amdgcn_sched_barrier(0);
        float x26 = GDN_RHS(26); { const v4f l0 = GDN_L4(26, 0); const v4f l1 = GDN_L4(26, 1); const v4f l2 = GDN_L4(26, 2); const v4f l3 = GDN_L4(26, 3); const v4f l4 = GDN_L4(26, 4); const v4f l5 = GDN_L4(26, 5); __builtin_amdgcn_sched_barrier(0); x26 -= l0.x * x0; x26 -= l0.y * x1; x26 -= l0.z * x2; x26 -= l0.w * x3; x26 -= l1.x * x4; x26 -= l1.y * x5; x26 -= l1.z * x6; x26 -= l1.w * x7; x26 -= l2.x * x8; x26 -= l2.y * x9; x26 -= l2.z * x10; x26 -= l2.w * x11; x26 -= l3.x * x12; x26 -= l3.y * x13; x26 -= l3.z * x14; x26 -= l3.w * x15; x26 -= l4.x * x16; x26 -= l4.y * x17; x26 -= l4.z * x18; x26 -= l4.w * x19; x26 -= l5.x * x20; x26 -= l5.y * x21; x26 -= l5.z * x22; x26 -= l5.w * x23; } __builtin_amdgcn_sched_barrier(0); { const v4f l6 = GDN_L4(26, 6); __builtin_amdgcn_sched_barrier(0); x26 -= l6.x * x24; x26 -= l6.y * x25; } __builtin_amdgcn_sched_barrier(0);
        float x27 = GDN_RHS(27); { const v4f l0 = GDN_L4(27, 0); const v4f l1 = GDN_L4(27, 1); const v4f l2 = GDN_L4(27, 2); const v4f l3 = GDN_L4(27, 3); const v4f l4 = GDN_L4(27, 4); const v4f l5 = GDN_L4(27, 5); __builtin_amdgcn_sched_barrier(0); x27 -= l0.x * x0; x27 -= l0.y * x1; x27 -= l0.z * x2; x27 -= l0.w * x3; x27 -= l1.x * x4; x27 -= l1.y * x5; x27 -= l1.z * x6; x27 -= l1.w * x7; x27 -= l2.x * x8; x27 -= l2.y * x9; x27 -= l2.z * x10; x27 -= l2.w * x11; x27 -= l3.x * x12; x27 -= l3.y * x13; x27 -= l3.z * x14; x27 -= l3.w * x15; x27 -= l4.x * x16; x27 -= l4.y * x17; x27 -= l4.z * x18; x27 -= l4.w * x19; x27 -= l5.x * x20; x27 -= l5.y * x21; x27 -= l5.z * x22; x27 -= l5.w * x23; } __builtin_amdgcn_sched_barrier(0); { const v4f l6 = GDN_L4(27, 6); __builtin_amdgcn_sched_barrier(0); x27 -= l6.x * x24; x27 -= l6.y * x25; x27 -= l6.z * x26; } __builtin_amdgcn_sched_barrier(0);
        float x28 = GDN_RHS(28); { const v4f l0 = GDN_L4(28, 0); const v4f l1 = GDN_L4(28, 1); const v4f l2 = GDN_L4(28, 2); const v4f l3 = GDN_L4(28, 3); const v4f l4 = GDN_L4(28, 4); const v4f l5 = GDN_L4(28, 5); __builtin_amdgcn_sched_barrier(0); x28 -= l0.x * x0; x28 -= l0.y * x1; x28 -= l0.z * x2; x28 -= l0.w * x3; x28 -= l1.x * x4; x28 -= l1.y * x5; x28 -= l1.z * x6; x28 -= l1.w * x7; x28 -= l2.x * x8; x28 -= l2.y * x9; x28 -= l2.z * x10; x28 -= l2.w * x11; x28 -= l3.x * x12; x28 -= l3.y * x13; x28 -= l3.z * x14; x28 -= l3.w * x15; x28 -= l4.x * x16; x28 -= l4.y * x17; x28 -= l4.z * x18; x28 -= l4.w * x19; x28 -= l5.x * x20; x28 -= l5.y * x21; x28 -= l5.z * x22; x28 -= l5.w * x23; } __builtin_amdgcn_sched_barrier(0); { const v4f l6 = GDN_L4(28, 6); __builtin_amdgcn_sched_barrier(0); x28 -= l6.x * x24; x28 -= l6.y * x25; x28 -= l6.z * x26; x28 -= l6.w * x27; } __builtin_amdgcn_sched_barrier(0);
        float x29 = GDN_RHS(29); { const v4f l0 = GDN_L4(29, 0); const v4f l1 = GDN_L4(29, 1); const v4f l2 = GDN_L4(29, 2); const v4f l3 = GDN_L4(29, 3); const v4f l4 = GDN_L4(29, 4); const v4f l5 = GDN_L4(29, 5); __builtin_amdgcn_sched_barrier(0); x29 -= l0.x * x0; x29 -= l0.y * x1; x29 -= l0.z * x2; x29 -= l0.w * x3; x29 -= l1.x * x4; x29 -= l1.y * x5; x29 -= l1.z * x6; x29 -= l1.w * x7; x29 -= l2.x * x8; x29 -= l2.y * x9; x29 -= l2.z * x10; x29 -= l2.w * x11; x29 -= l3.x * x12; x29 -= l3.y * x13; x29 -= l3.z * x14; x29 -= l3.w * x15; x29 -= l4.x * x16; x29 -= l4.y * x17; x29 -= l4.z * x18; x29 -= l4.w * x19; x29 -= l5.x * x20; x29 -= l5.y * x21; x29 -= l5.z * x22; x29 -= l5.w * x23; } __builtin_amdgcn_sched_barrier(0); { const v4f l6 = GDN_L4(29, 6); const v4f l7 = GDN_L4(29, 7); __builtin_amdgcn_sched_barrier(0); x29 -= l6.x * x24; x29 -= l6.y * x25; x29 -= l6.z * x26; x29 -= l6.w * x27; x29 -= l7.x * x28; } __builtin_amdgcn_sched_barrier(0);
        float x30 = GDN_RHS(30); { const v4f l0 = GDN_L4(30, 0); const v4f l1 = GDN_L4(30, 1); const v4f l2 = GDN_L4(30, 2); const v4f l3 = GDN_L4(30, 3); const v4f l4 = GDN_L4(30, 4); const v4f l5 = GDN_L4(30, 5); __builtin_amdgcn_sched_barrier(0); x30 -= l0.x * x0; x30 -= l0.y * x1; x30 -= l0.z * x2; x30 -= l0.w * x3; x30 -= l1.x * x4; x30 -= l1.y * x5; x30 -= l1.z * x6; x30 -= l1.w * x7; x30 -= l2.x * x8; x30 -= l2.y * x9; x30 -= l2.z * x10; x30 -= l2.w * x11; x30 -= l3.x * x12; x30 -= l3.y * x13; x30 -= l3.z * x14; x30 -= l3.w * x15; x30 -= l4.x * x16; x30 -= l4.y * x17; x30 -= l4.z * x18; x30 -= l4.w * x19; x30 -= l5.x * x20; x30 -= l5.y * x21; x30 -= l5.z * x22; x30 -= l5.w * x23; } __builtin_amdgcn_sched_barrier(0); { const v4f l6 = GDN_L4(30, 6); const v4f l7 = GDN_L4(30, 7); __builtin_amdgcn_sched_barrier(0); x30 -= l6.x * x24; x30 -= l6.y * x25; x30 -= l6.z * x26; x30 -= l6.w * x27; x30 -= l7.x * x28; x30 -= l7.y * x29; } __builtin_amdgcn_sched_barrier(0);
        float x31 = GDN_RHS(31); { const v4f l0 = GDN_L4(31, 0); const v4f l1 = GDN_L4(31, 1); const v4f l2 = GDN_L4(31, 2); const v4f l3 = GDN_L4(31, 3); const v4f l4 = GDN_L4(31, 4); const v4f l5 = GDN_L4(31, 5); __builtin_amdgcn_sched_barrier(0); x31 -= l0.x * x0; x31 -= l0.y * x1; x31 -= l0.z * x2; x31 -= l0.w * x3; x31 -= l1.x * x4; x31 -= l1.y * x5; x31 -= l1.z * x6; x31 -= l1.w * x7; x31 -= l2.x * x8; x31 -= l2.y * x9; x31 -= l2.z * x10; x31 -= l2.w * x11; x31 -= l3.x * x12; x31 -= l3.y * x13; x31 -= l3.z * x14; x31 -= l3.w * x15; x31 -= l4.x * x16; x31 -= l4.y * x17; x31 -= l4.z * x18; x31 -= l4.w * x19; x31 -= l5.x * x20; x31 -= l5.y * x21; x31 -= l5.z * x22; x31 -= l5.w * x23; } __builtin_amdgcn_sched_barrier(0); { const v4f l6 = GDN_L4(31, 6); const v4f l7 = GDN_L4(31, 7); __builtin_amdgcn_sched_barrier(0); x31 -= l6.x * x24; x31 -= l6.y * x25; x31 -= l6.z * x26; x31 -= l6.w * x27; x31 -= l7.x * x28; x31 -= l7.y * x29; x31 -= l7.z * x30; } __builtin_amdgcn_sched_barrier(0);
        float x32 = GDN_RHS(32); { const v4f l0 = GDN_L4(32, 0); const v4f l1 = GDN_L4(32, 1); const v4f l2 = GDN_L4(32, 2); const v4f l3 = GDN_L4(32, 3); const v4f l4 = GDN_L4(32, 4); const v4f l5 = GDN_L4(32, 5); __builtin_amdgcn_sched_barrier(0); x32 -= l0.x * x0; x32 -= l0.y * x1; x32 -= l0.z * x2; x32 -= l0.w * x3; x32 -= l1.x * x4; x32 -= l1.y * x5; x32 -= l1.z * x6; x32 -= l1.w * x7; x32 -= l2.x * x8; x32 -= l2.y * x9; x32 -= l2.z * x10; x32 -= l2.w * x11; x32 -= l3.x * x12; x32 -= l3.y * x13; x32 -= l3.z * x14; x32 -= l3.w * x15; x32 -= l4.x * x16; x32 -= l4.y * x17; x32 -= l4.z * x18; x32 -= l4.w * x19; x32 -= l5.x * x20; x32 -= l5.y * x21; x32 -= l5.z * x22; x32 -= l5.w * x23; } __builtin_amdgcn_sched_barrier(0); { const v4f l6 = GDN_L4(32, 6); const v4f l7 = GDN_L4(32, 7); __builtin_amdgcn_sched_barrier(0); x32 -= l6.x * x24; x32 -= l6.y * x25; x32 -= l6.z * x26; x32 -= l6.w * x27; x32 -= l7.x * x28; x32 -= l7.y * x29; x32 -= l7.z * x30; x32 -= l7.w * x31; } __builtin_amdgcn_sched_barrier(0);
        float x33 = GDN_RHS(33); { const v4f l0 = GDN_L4(33, 0); const v4f l1 = GDN_L4(33, 1); const v4f l2 = GDN_L4(33, 2); const v4f l3 = GDN_L4(33, 3); const v4f l4 = GDN_L4(33, 4); const v4f l5 = GDN_L4(33, 5); __builtin_amdgcn_sched_barrier(0); x33 -= l0.x * x0; x33 -= l0.y * x1; x33 -= l0.z * x2; x33 -= l0.w * x3; x33 -= l1.x * x4; x33 -= l1.y * x5; x33 -= l1.z * x6; x33 -= l1.w * x7; x33 -= l2.x * x8; x33 -= l2.y * x9; x33 -= l2.z * x10; x33 -= l2.w * x11; x33 -= l3.x * x12; x33 -= l3.y * x13; x33 -= l3.z * x14; x33 -= l3.w * x15; x33 -= l4.x * x16; x33 -= l4.y * x17; x33 -= l4.z * x18; x33 -= l4.w * x19; x33 -= l5.x * x20; x33 -= l5.y * x21; x33 -= l5.z * x22; x33 -= l5.w * x23; } __builtin_amdgcn_sched_barrier(0); { const v4f l6 = GDN_L4(33, 6); const v4f l7 = GDN_L4(33, 7); const v4f l8 = GDN_L4(33, 8); __builtin_amdgcn_sched_barrier(0); x33 -= l6.x * x24; x33 -= l6.y * x25; x33 -= l6.z * x26; x33 -= l6.w * x27; x33 -= l7.x * x28; x33 -= l7.y * x29; x33 -= l7.z * x30; x33 -= l7.w * x31; x33 -= l8.x * x32; } __builtin_amdgcn_sched_barrier(0);
        float x34 = GDN_RHS(34); { const v4f l0 = GDN_L4(34, 0); const v4f l1 = GDN_L4(34, 1); const v4f l2 = GDN_L4(34, 2); const v4f l3 = GDN_L4(34, 3); const v4f l4 = GDN_L4(34, 4); const v4f l5 = GDN_L4(34, 5); __builtin_amdgcn_sched_barrier(0); x34 -= l0.x * x0; x34 -= l0.y * x1; x34 -= l0.z * x2; x34 -= l0.w * x3; x34 -= l1.x * x4; x34 -= l1.y * x5; x34 -= l1.z * x6; x34 -= l1.w * x7; x34 -= l2.x * x8; x34 -= l2.y * x9; x34 -= l2.z * x10; x34 -= l2.w * x11; x34 -= l3.x * x12; x34 -= l3.y * x13; x34 -= l3.z * x14; x34 -= l3.w * x15; x34 -= l4.x * x16; x34 -= l4.y * x17; x34 -= l4.z * x18; x34 -= l4.w * x19; x34 -= l5.x * x20; x34 -= l5.y * x21; x34 -= l5.z * x22; x34 -= l5.w * x23; } __builtin_amdgcn_sched_barrier(0); { const v4f l6 = GDN_L4(34, 6); const v4f l7 = GDN_L4(34, 7); const v4f l8 = GDN_L4(34, 8); __builtin_amdgcn_sched_barrier(0); x34 -= l6.x * x24; x34 -= l6.y * x25; x34 -= l6.z * x26; x34 -= l6.w * x27; x34 -= l7.x * x28; x34 -= l7.y * x29; x34 -= l7.z * x30; x34 -= l7.w * x31; x34 -= l8.x * x32; x34 -= l8.y * x33; } __builtin_amdgcn_sched_barrier(0);
        float x35 = GDN_RHS(35); { const v4f l0 = GDN_L4(35, 0); const v4f l1 = GDN_L4(35, 1); const v4f l2 = GDN_L4(35, 2); const v4f l3 = GDN_L4(35, 3); const v4f l4 = GDN_L4(35, 4); const v4f l5 = GDN_L4(35, 5); __builtin_amdgcn_sched_barrier(0); x35 -= l0.x * x0; x35 -= l0.y * x1; x35 -= l0.z * x2; x35 -= l0.w * x3; x35 -= l1.x * x4; x35 -= l1.y * x5; x35 -= l1.z * x6; x35 -= l1.w * x7; x35 -= l2.x * x8; x35 -= l2.y * x9; x35 -= l2.z * x10; x35 -= l2.w * x11; x35 -= l3.x * x12; x35 -= l3.y * x13; x35 -= l3.z * x14; x35 -= l3.w * x15; x35 -= l4.x * x16; x35 -= l4.y * x17; x35 -= l4.z * x18; x35 -= l4.w * x19; x35 -= l5.x * x20; x35 -= l5.y * x21; x35 -= l5.z * x22; x35 -= l5.w * x23; } __builtin_amdgcn_sched_barrier(0); { const v4f l6 = GDN_L4(35, 6); const v4f l7 = GDN_L4(35, 7); const v4f l8 = GDN_L4(35, 8); __builtin_amdgcn_sched_barrier(0); x35 -= l6.x * x24; x35 -= l6.y * x25; x35 -= l6.z * x26; x35 -= l6.w * x27; x35 -= l7.x * x28; x35 -= l7.y * x29; x35 -= l7.z * x30; x35 -= l7.w * x31; x35 -= l8.x * x32; x35 -= l8.y * x33; x35 -= l8.z * x34; } __builtin_amdgcn_sched_barrier(0);
        float x36 = GDN_RHS(36); { const v4f l0 = GDN_L4(36, 0); const v4f l1 = GDN_L4(36, 1); const v4f l2 = GDN_L4(36, 2); const v4f l3 = GDN_L4(36, 3); const v4f l4 = GDN_L4(36, 4); const v4f l5 = GDN_L4(36, 5); __builtin_amdgcn_sched_barrier(0); x36 -= l0.x * x0; x36 -= l0.y * x1; x36 -= l0.z * x2; x36 -= l0.w * x3; x36 -= l1.x * x4; x36 -= l1.y * x5; x36 -= l1.z * x6; x36 -= l1.w * x7; x36 -= l2.x * x8; x36 -= l2.y * x9; x36 -= l2.z * x10; x36 -= l2.w * x11; x36 -= l3.x * x12; x36 -= l3.y * x13; x36 -= l3.z * x14; x36 -= l3.w * x15; x36 -= l4.x * x16; x36 -= l4.y * x17; x36 -= l4.z * x18; x36 -= l4.w * x19; x36 -= l5.x * x20; x36 -= l5.y * x21; x36 -= l5.z * x22; x36 -= l5.w * x23; } __builtin_amdgcn_sched_barrier(0); { const v4f l6 = GDN_L4(36, 6); const v4f l7 = GDN_L4(36, 7); const v4f l8 = GDN_L4(36, 8); __builtin_amdgcn_sched_barrier(0); x36 -= l6.x * x24; x36 -= l6.y * x25; x36 -= l6.z * x26; x36 -= l6.w * x27; x36 -= l7.x * x28; x36 -= l7.y * x29; x36 -= l7.z * x30; x36 -= l7.w * x31; x36 -= l8.x * x32; x36 -= l8.y * x33; x36 -= l8.z * x34; x36 -= l8.w * x35; } __builtin_amdgcn_sched_barrier(0);
        float x37 = GDN_RHS(37); { const v4f l0 = GDN_L4(37, 0); const v4f l1 = GDN_L4(37, 1); const v4f l2 = GDN_L4(37, 2); const v4f l3 = GDN_L4(37, 3); const v4f l4 = GDN_L4(37, 4); const v4f l5 = GDN_L4(37, 5); __builtin_amdgcn_sched_barrier(0); x37 -= l0.x * x0; x37 -= l0.y * x1; x37 -= l0.z * x2; x37 -= l0.w * x3; x37 -= l1.x * x4; x37 -= l1.y * x5; x37 -= l1.z * x6; x37 -= l1.w * x7; x37 -= l2.x * x8; x37 -= l2.y * x9; x37 -= l2.z * x10; x37 -= l2.w * x11; x37 -= l3.x * x12; x37 -= l3.y * x13; x37 -= l3.z * x14; x37 -= l3.w * x15; x37 -= l4.x * x16; x37 -= l4.y * x17; x37 -= l4.z * x18; x37 -= l4.w * x19; x37 -= l5.x * x20; x37 -= l5.y * x21; x37 -= l5.z * x22; x37 -= l5.w * x23; } __builtin_amdgcn_sched_barrier(0); { const v4f l6 = GDN_L4(37, 6); const v4f l7 = GDN_L4(37, 7); const v4f l8 = GDN_L4(37, 8); const v4f l9 = GDN_L4(37, 9); __builtin_amdgcn_sched_barrier(0); x37 -= l6.x * x24; x37 -= l6.y * x25; x37 -= l6.z * x26; x37 -= l6.w * x27; x37 -= l7.x * x28; x37 -= l7.y * x29; x37 -= l7.z * x30; x37 -= l7.w * x31; x37 -= l8.x * x32; x37 -= l8.y * x33; x37 -= l8.z * x34; x37 -= l8.w * x35; x37 -= l9.x * x36; } __builtin_amdgcn_sched_barrier(0);
        float x38 = GDN_RHS(38); { const v4f l0 = GDN_L4(38, 0); const v4f l1 = GDN_L4(38, 1); const v4f l2 = GDN_L4(38, 2); const v4f l3 = GDN_L4(38, 3); const v4f l4 = GDN_L4(38, 4); const v4f l5 = GDN_L4(38, 5); __builtin_amdgcn_sched_barrier(0); x38 -= l0.x * x0; x38 -= l0.y * x1; x38 -= l0.z * x2; x38 -= l0.w * x3; x38 -= l1.x * x4; x38 -= l1.y * x5; x38 -= l1.z * x6; x38 -= l1.w * x7; x38 -= l2.x * x8; x38 -= l2.y * x9; x38 -= l2.z * x10; x38 -= l2.w * x11; x38 -= l3.x * x12; x38 -= l3.y * x13; x38 -= l3.z * x14; x38 -= l3.w * x15; x38 -= l4.x * x16; x38 -= l4.y * x17; x38 -= l4.z * x18; x38 -= l4.w * x19; x38 -= l5.x * x20; x38 -= l5.y * x21; x38 -= l5.z * x22; x38 -= l5.w * x23; } __builtin_amdgcn_sched_barrier(0); { const v4f l6 = GDN_L4(38, 6); const v4f l7 = GDN_L4(38, 7); const v4f l8 = GDN_L4(38, 8); const v4f l9 = GDN_L4(38, 9); __builtin_amdgcn_sched_barrier(0); x38 -= l6.x * x24; x38 -= l6.y * x25; x38 -= l6.z * x26; x38 -= l6.w * x27; x38 -= l7.x * x28; x38 -= l7.y * x29; x38 -= l7.z * x30; x38 -= l7.w * x31; x38 -= l8.x * x32; x38 -= l8.y * x33; x38 -= l8.z * x34; x38 -= l8.w * x35; x38 -= l9.x * x36; x38 -= l9.y * x37; } __builtin_amdgcn_sched_barrier(0);
        float x39 = GDN_RHS(39); { const v4f l0 = GDN_L4(39, 0); const v4f l1 = GDN_L4(39, 1); const v4f l2 = GDN_L4(39, 2); const v4f l3 = GDN_L4(39, 3); const v4f l4 = GDN_L4(39, 4); const v4f l5 = GDN_L4(39, 5); __builtin_amdgcn_sched_barrier(0); x39 -= l0.x * x0; x39 -= l0.y * x1; x39 -= l0.z * x2; x39 -= l0.w * x3; x39 -= l1.x * x4; x39 -= l1.y * x5; x39 -= l1.z * x6; x39 -= l1.w * x7; x39 -= l2.x * x8; x39 -= l2.y * x9; x39 -= l2.z * x10; x39 -= l2.w * x11; x39 -= l3.x * x12; x39 -= l3.y * x13; x39 -= l3.z * x14; x39 -= l3.w * x15; x39 -= l4.x * x16; x39 -= l4.y * x17; x39 -= l4.z * x18; x39 -= l4.w * x19; x39 -= l5.x * x20; x39 -= l5.y * x21; x39 -= l5.z * x22; x39 -= l5.w * x23; } __builtin_amdgcn_sched_barrier(0); { const v4f l6 = GDN_L4(39, 6); const v4f l7 = GDN_L4(39, 7); const v4f l8 = GDN_L4(39, 8); const v4f l9 = GDN_L4(39, 9); __builtin_amdgcn_sched_barrier(0); x39 -= l6.x * x24; x39 -= l6.y * x25; x39 -= l6.z * x26; x39 -= l6.w * x27; x39 -= l7.x * x28; x39 -= l7.y * x29; x39 -= l7.z * x30; x39 -= l7.w * x31; x39 -= l8.x * x32; x39 -= l8.y * x33; x39 -= l8.z * x34; x39 -= l8.w * x35; x39 -= l9.x * x36; x39 -= l9.y * x37; x39 -= l9.z * x38; } __builtin_amdgcn_sched_barrier(0);
        float x40 = GDN_RHS(40); { const v4f l0 = GDN_L4(40, 0); const v4f l1 = GDN_L4(40, 1); const v4f l2 = GDN_L4(40, 2); const v4f l3 = GDN_L4(40, 3); const v4f l4 = GDN_L4(40, 4); const v4f l5 = GDN_L4(40, 5); __builtin_amdgcn_sched_barrier(0); x40 -= l0.x * x0; x40 -= l0.y * x1; x40 -= l0.z * x2; x40 -= l0.w * x3; x40 -= l1.x * x4; x40 -= l1.y * x5; x40 -= l1.z * x6; x40 -= l1.w * x7; x40 -= l2.x * x8; x40 -= l2.y * x9; x40 -= l2.z * x10; x40 -= l2.w * x11; x40 -= l3.x * x12; x40 -= l3.y * x13; x40 -= l3.z * x14; x40 -= l3.w * x15; x40 -= l4.x * x16; x40 -= l4.y * x17; x40 -= l4.z * x18; x40 -= l4.w * x19; x40 -= l5.x * x20; x40 -= l5.y * x21; x40 -= l5.z * x22; x40 -= l5.w * x23; } __builtin_amdgcn_sched_barrier(0); { const v4f l6 = GDN_L4(40, 6); const v4f l7 = GDN_L4(40, 7); const v4f l8 = GDN_L4(40, 8); const v4f l9 = GDN_L4(40, 9); __builtin_amdgcn_sched_barrier(0); x40 -= l6.x * x24; x40 -= l6.y * x25; x40 -= l6.z * x26; x40 -= l6.w * x27; x40 -= l7.x * x28; x40 -= l7.y * x29; x40 -= l7.z * x30; x40 -= l7.w * x31; x40 -= l8.x * x32; x40 -= l8.y * x33; x40 -= l8.z * x34; x40 -= l8.w * x35; x40 -= l9.x * x36; x40 -= l9.y * x37; x40 -= l9.z * x38; x40 -= l9.w * x39; } __builtin_amdgcn_sched_barrier(0);
        float x41 = GDN_RHS(41); { const v4f l0 = GDN_L4(41, 0); const v4f l1 = GDN_L4(41, 1); const v4f l2 = GDN_L4(41, 2); const v4f l3 = GDN_L4(41, 3); const v4f l4 = GDN_L4(41, 4); const v4f l5 = GDN_L4(41, 5); __builtin_amdgcn_sched_barrier(0); x41 -= l0.x * x0; x41 -= l0.y * x1; x41 -= l0.z * x2; x41 -= l0.w * x3; x41 -= l1.x * x4; x41 -= l1.y * x5; x41 -= l1.z * x6; x41 -= l1.w * x7; x41 -= l2.x * x8; x41 -= l2.y * x9; x41 -= l2.z * x10; x41 -= l2.w * x11; x41 -= l3.x * x12; x41 -= l3.y * x13; x41 -= l3.z * x14; x41 -= l3.w * x15; x41 -= l4.x * x16; x41 -= l4.y * x17; x41 -= l4.z * x18; x41 -= l4.w * x19; x41 -= l5.x * x20; x41 -= l5.y * x21; x41 -= l5.z * x22; x41 -= l5.w * x23; } __builtin_amdgcn_sched_barrier(0); { const v4f l6 = GDN_L4(41, 6); const v4f l7 = GDN_L4(41, 7); const v4f l8 = GDN_L4(41, 8); const v4f l9 = GDN_L4(41, 9); const v4f l10 = GDN_L4(41, 10); __builtin_amdgcn_sched_barrier(0); x41 -= l6.x * x24; x41 -= l6.y * x25; x41 -= l6.z * x26; x41 -= l6.w * x27; x41 -= l7.x * x28; x41 -= l7.y * x29; x41 -= l7.z * x30; x41 -= l7.w * x31; x41 -= l8.x * x32; x41 -= l8.y * x33; x41 -= l8.z * x34; x41 -= l8.w * x35; x41 -= l9.x * x36; x41 -= l9.y * x37; x41 -= l9.z * x38; x41 -= l9.w * x39; x41 -= l10.x * x40; } __builtin_amdgcn_sched_barrier(0);
        float x42 = GDN_RHS(42); { const v4f l0 = GDN_L4(42, 0); const v4f l1 = GDN_L4(42, 1); const v4f l2 = GDN_L4(42, 2); const v4f l3 = GDN_L4(42, 3); const v4f l4 = GDN_L4(42, 4); const v4f l5 = GDN_L4(42, 5); __builtin_amdgcn_sched_barrier(0); x42 -= l0.x * x0; x42 -= l0.y * x1; x42 -= l0.z * x2; x42 -= l0.w * x3; x42 -= l1.x * x4; x42 -= l1.y * x5; x42 -= l1.z * x6; x42 -= l1.w * x7; x42 -= l2.x * x8; x42 -= l2.y * x9; x42 -= l2.z * x10; x42 -= l2.w * x11; x42 -= l3.x * x12; x42 -= l3.y * x13; x42 -= l3.z * x14; x42 -= l3.w * x15; x42 -= l4.x * x16; x42 -= l4.y * x17; x42 -= l4.z * x18; x42 -= l4.w * x19; x42 -= l5.x * x20; x42 -= l5.y * x21; x42 -= l5.z * x22; x42 -= l5.w * x23; } __builtin_amdgcn_sched_barrier(0); { const v4f l6 = GDN_L4(42, 6); const v4f l7 = GDN_L4(42, 7); const v4f l8 = GDN_L4(42, 8); const v4f l9 = GDN_L4(42, 9); const v4f l10 = GDN_L4(42, 10); __builtin_amdgcn_sched_barrier(0); x42 -= l6.x * x24; x42 -= l6.y * x25; x42 -= l6.z * x26; x42 -= l6.w * x27; x42 -= l7.x * x28; x42 -= l7.y * x29; x42 -= l7.z * x30; x42 -= l7.w * x31; x42 -= l8.x * x32; x42 -= l8.y * x33; x42 -= l8.z * x34; x42 -= l8.w * x35; x42 -= l9.x * x36; x42 -= l9.y * x37; x42 -= l9.z * x38; x42 -= l9.w * x39; x42 -= l10.x * x40; x42 -= l10.y * x41; } __builtin_amdgcn_sched_barrier(0);
        float x43 = GDN_RHS(43); { const v4f l0 = GDN_L4(43, 0); const v4f l1 = GDN_L4(43, 1); const v4f l2 = GDN_L4(43, 2); const v4f l3 = GDN_L4(43, 3); const v4f l4 = GDN_L4(43, 4); const v4f l5 = GDN_L4(43, 5); __builtin_amdgcn_sched_barrier(0); x43 -= l0.x * x0; x43 -= l0.y * x1; x43 -= l0.z * x2; x43 -= l0.w * x3; x43 -= l1.x * x4; x43 -= l1.y * x5; x43 -= l1.z * x6; x43 -= l1.w * x7; x43 -= l2.x * x8; x43 -= l2.y * x9; x43 -= l2.z * x10; x43 -= l2.w * x11; x43 -= l3.x * x12; x43 -= l3.y * x13; x43 -= l3.z * x14; x43 -= l3.w * x15; x43 -= l4.x * x16; x43 -= l4.y * x17; x43 -= l4.z * x18; x43 -= l4.w * x19; x43 -= l5.x * x20; x43 -= l5.y * x21; x43 -= l5.z * x22; x43 -= l5.w * x23; } __builtin_amdgcn_sched_barrier(0); { const v4f l6 = GDN_L4(43, 6); const v4f l7 = GDN_L4(43, 7); const v4f l8 = GDN_L4(43, 8); const v4f l9 = GDN_L4(43, 9); const v4f l10 = GDN_L4(43, 10); __builtin_amdgcn_sched_barrier(0); x43 -= l6.x * x24; x43 -= l6.y * x25; x43 -= l6.z * x26; x43 -= l6.w * x27; x43 -= l7.x * x28; x43 -= l7.y * x29; x43 -= l7.z * x30; x43 -= l7.w * x31; x43 -= l8.x * x32; x43 -= l8.y * x33; x43 -= l8.z * x34; x43 -= l8.w * x35; x43 -= l9.x * x36; x43 -= l9.y * x37; x43 -= l9.z * x38; x43 -= l9.w * x39; x43 -= l10.x * x40; x43 -= l10.y * x41; x43 -= l10.z * x42; } __builtin_amdgcn_sched_barrier(0);
        float x44 = GDN_RHS(44); { const v4f l0 = GDN_L4(44, 0); const v4f l1 = GDN_L4(44, 1); const v4f l2 = GDN_L4(44, 2); const v4f l3 = GDN_L4(44, 3); const v4f l4 = GDN_L4(44, 4); const v4f l5 = GDN_L4(44, 5); __builtin_amdgcn_sched_barrier(0); x44 -= l0.x * x0; x44 -= l0.y * x1; x44 -= l0.z * x2; x44 -= l0.w * x3; x44 -= l1.x * x4; x44 -= l1.y * x5; x44 -= l1.z * x6; x44 -= l1.w * x7; x44 -= l2.x * x8; x44 -= l2.y * x9; x44 -= l2.z * x10; x44 -= l2.w * x11; x44 -= l3.x * x12; x44 -= l3.y * x13; x44 -= l3.z * x14; x44 -= l3.w * x15; x44 -= l4.x * x16; x44 -= l4.y * x17; x44 -= l4.z * x18; x44 -= l4.w * x19; x44 -= l5.x * x20; x44 -= l5.y * x21; x44 -= l5.z * x22; x44 -= l5.w * x23; } __builtin_amdgcn_sched_barrier(0); { const v4f l6 = GDN_L4(44, 6); const v4f l7 = GDN_L4(44, 7); const v4f l8 = GDN_L4(44, 8); const v4f l9 = GDN_L4(44, 9); const v4f l10 = GDN_L4(44, 10); __builtin_amdgcn_sched_barrier(0); x44 -= l6.x * x24; x44 -= l6.y * x25; x44 -= l6.z * x26; x44 -= l6.w * x27; x44 -= l7.x * x28; x44 -= l7.y * x29; x44 -= l7.z * x30; x44 -= l7.w * x31; x44 -= l8.x * x32; x44 -= l8.y * x33; x44 -= l8.z * x34; x44 -= l8.w * x35; x44 -= l9.x * x36; x44 -= l9.y * x37; x44 -= l9.z * x38; x44 -= l9.w * x39; x44 -= l10.x * x40; x44 -= l10.y * x41; x44 -= l10.z * x42; x44 -= l10.w * x43; } __builtin_amdgcn_sched_barrier(0);
        float x45 = GDN_RHS(45); { const v4f l0 = GDN_L4(45, 0); const v4f l1 = GDN_L4(45, 1); const v4f l2 = GDN_L4(45, 2); const v4f l3 = GDN_L4(45, 3); const v4f l4 = GDN_L4(45, 4); const v4f l5 = GDN_L4(45, 5); __builtin_amdgcn_sched_barrier(0); x45 -= l0.x * x0; x45 -= l0.y * x1; x45 -= l0.z * x2; x45 -= l0.w * x3; x45 -= l1.x * x4; x45 -= l1.y * x5; x45 -= l1.z * x6; x45 -= l1.w * x7; x45 -= l2.x * x8; x45 -= l2.y * x9; x45 -= l2.z * x10; x45 -= l2.w * x11; x45 -= l3.x * x12; x45 -= l3.y * x13; x45 -= l3.z * x14; x45 -= l3.w * x15; x45 -= l4.x * x16; x45 -= l4.y * x17; x45 -= l4.z * x18; x45 -= l4.w * x19; x45 -= l5.x * x20; x45 -= l5.y * x21; x45 -= l5.z * x22; x45 -= l5.w * x23; } __builtin_amdgcn_sched_barrier(0); { const v4f l6 = GDN_L4(45, 6); const v4f l7 = GDN_L4(45, 7); const v4f l8 = GDN_L4(45, 8); const v4f l9 = GDN_L4(45, 9); const v4f l10 = GDN_L4(45, 10); const v4f l11 = GDN_L4(45, 11); __builtin_amdgcn_sched_barrier(0); x45 -= l6.x * x24; x45 -= l6.y * x25; x45 -= l6.z * x26; x45 -= l6.w * x27; x45 -= l7.x * x28; x45 -= l7.y * x29; x45 -= l7.z * x30; x45 -= l7.w * x31; x45 -= l8.x * x32; x45 -= l8.y * x33; x45 -= l8.z * x34; x45 -= l8.w * x35; x45 -= l9.x * x36; x45 -= l9.y * x37; x45 -= l9.z * x38; x45 -= l9.w * x39; x45 -= l10.x * x40; x45 -= l10.y * x41; x45 -= l10.z * x42; x45 -= l10.w * x43; x45 -= l11.x * x44; } __builtin_amdgcn_sched_barrier(0);
        float x46 = GDN_RHS(46); { const v4f l0 = GDN_L4(46, 0); const v4f l1 = GDN_L4(46, 1); const v4f l2 = GDN_L4(46, 2); const v4f l3 = GDN_L4(46, 3); const v4f l4 = GDN_L4(46, 4); const v4f l5 = GDN_L4(46, 5); __builtin_amdgcn_sched_barrier(0); x46 -= l0.x * x0; x46 -= l0.y * x1; x46 -= l0.z * x2; x46 -= l0.w * x3; x46 -= l1.x * x4; x46 -= l1.y * x5; x46 -= l1.z * x6; x46 -= l1.w * x7; x46 -= l2.x * x8; x46 -= l2.y * x9; x46 -= l2.z * x10; x46 -= l2.w * x11; x46 -= l3.x * x12; x46 -= l3.y * x13; x46 -= l3.z * x14; x46 -= l3.w * x15; x46 -= l4.x * x16; x46 -= l4.y * x17; x46 -= l4.z * x18; x46 -= l4.w * x19; x46 -= l5.x * x20; x46 -= l5.y * x21; x46 -= l5.z * x22; x46 -= l5.w * x23; } __builtin_amdgcn_sched_barrier(0); { const v4f l6 = GDN_L4(46, 6); const v4f l7 = GDN_L4(46, 7); const v4f l8 = GDN_L4(46, 8); const v4f l9 = GDN_L4(46, 9); const v4f l10 = GDN_L4(46, 10); const v4f l11 = GDN_L4(46, 11); __builtin_amdgcn_sched_barrier(0); x46 -= l6.x * x24; x46 -= l6.y * x25; x46 -= l6.z * x26; x46 -= l6.w * x27; x46 -= l7.x * x28; x46 -= l7.y * x29; x46 -= l7.z * x30; x46 -= l7.w * x31; x46 -= l8.x * x32; x46 -= l8.y * x33; x46 -= l8.z * x34; x46 -= l8.w * x35; x46 -= l9.x * x36; x46 -= l9.y * x37; x46 -= l9.z * x38; x46 -= l9.w * x39; x46 -= l10.x * x40; x46 -= l10.y * x41; x46 -= l10.z * x42; x46 -= l10.w * x43; x46 -= l11.x * x44; x46 -= l11.y * x45; } __builtin_amdgcn_sched_barrier(0);
        float x47 = GDN_RHS(47); { const v4f l0 = GDN_L4(47, 0); const v4f l1 = GDN_L4(47, 1); const v4f l2 = GDN_L4(47, 2); const v4f l3 = GDN_L4(47, 3); const v4f l4 = GDN_L4(47, 4); const v4f l5 = GDN_L4(47, 5); __builtin_amdgcn_sched_barrier(0); x47 -= l0.x * x0; x47 -= l0.y * x1; x47 -= l0.z * x2; x47 -= l0.w * x3; x47 -= l1.x * x4; x47 -= l1.y * x5; x47 -= l1.z * x6; x47 -= l1.w * x7; x47 -= l2.x * x8; x47 -= l2.y * x9; x47 -= l2.z * x10; x47 -= l2.w * x11; x47 -= l3.x * x12; x47 -= l3.y * x13; x47 -= l3.z * x14; x47 -= l3.w * x15; x47 -= l4.x * x16; x47 -= l4.y * x17; x47 -= l4.z * x18; x47 -= l4.w * x19; x47 -= l5.x * x20; x47 -= l5.y * x21; x47 -= l5.z * x22; x47 -= l5.w * x23; } __builtin_amdgcn_sched_barrier(0); { const v4f l6 = GDN_L4(47, 6); const v4f l7 = GDN_L4(47, 7); const v4f l8 = GDN_L4(47, 8); const v4f l9 = GDN_L4(47, 9); const v4f l10 = GDN_L4(47, 10); const v4f l11 = GDN_L4(47, 11); __builtin_amdgcn_sched_barrier(0); x47 -= l6.x * x24; x47 -= l6.y * x25; x47 -= l6.z * x26; x47 -= l6.w * x27; x47 -= l7.x * x28; x47 -= l7.y * x29; x47 -= l7.z * x30; x47 -= l7.w * x31; x47 -= l8.x * x32; x47 -= l8.y * x33; x47 -= l8.z * x34; x47 -= l8.w * x35; x47 -= l9.x * x36; x47 -= l9.y * x37; x47 -= l9.z * x38; x47 -= l9.w * x39; x47 -= l10.x * x40; x47 -= l10.y * x41; x47 -= l10.z * x42; x47 -= l10.w * x43; x47 -= l11.x * x44; x47 -= l11.y * x45; x47 -= l11.z * x46; } __builtin_amdgcn_sched_barrier(0);
        float x48 = GDN_RHS(48); { const v4f l0 = GDN_L4(48, 0); const v4f l1 = GDN_L4(48, 1); const v4f l2 = GDN_L4(48, 2); const v4f l3 = GDN_L4(48, 3); const v4f l4 = GDN_L4(48, 4); const v4f l5 = GDN_L4(48, 5); __builtin_amdgcn_sched_barrier(0); x48 -= l0.x * x0; x48 -= l0.y * x1; x48 -= l0.z * x2; x48 -= l0.w * x3; x48 -= l1.x * x4; x48 -= l1.y * x5; x48 -= l1.z * x6; x48 -= l1.w * x7; x48 -= l2.x * x8; x48 -= l2.y * x9; x48 -= l2.z * x10; x48 -= l2.w * x11; x48 -= l3.x * x12; x48 -= l3.y * x13; x48 -= l3.z * x14; x48 -= l3.w * x15; x48 -= l4.x * x16; x48 -= l4.y * x17; x48 -= l4.z * x18; x48 -= l4.w * x19; x48 -= l5.x * x20; x48 -= l5.y * x21; x48 -= l5.z * x22; x48 -= l5.w * x23; } __builtin_amdgcn_sched_barrier(0); { const v4f l6 = GDN_L4(48, 6); const v4f l7 = GDN_L4(48, 7); const v4f l8 = GDN_L4(48, 8); const v4f l9 = GDN_L4(48, 9); const v4f l10 = GDN_L4(48, 10); const v4f l11 = GDN_L4(48, 11); __builtin_amdgcn_sched_barrier(0); x48 -= l6.x * x24; x48 -= l6.y * x25; x48 -= l6.z * x26; x48 -= l6.w * x27; x48 -= l7.x * x28; x48 -= l7.y * x29; x48 -= l7.z * x30; x48 -= l7.w * x31; x48 -= l8.x * x32; x48 -= l8.y * x33; x48 -= l8.z * x34; x48 -= l8.w * x35; x48 -= l9.x * x36; x48 -= l9.y * x37; x48 -= l9.z * x38; x48 -= l9.w * x39; x48 -= l10.x * x40; x48 -= l10.y * x41; x48 -= l10.z * x42; x48 -= l10.w * x43; x48 -= l11.x * x44; x48 -= l11.y * x45; x48 -= l11.z * x46; x48 -= l11.w * x47; } __builtin_amdgcn_sched_barrier(0);
        float x49 = GDN_RHS(49); { const v4f l0 = GDN_L4(49, 0); const v4f l1 = GDN_L4(49, 1); const v4f l2 = GDN_L4(49, 2); const v4f l3 = GDN_L4(49, 3); const v4f l4 = GDN_L4(49, 4); const v4f l5 = GDN_L4(49, 5); __builtin_amdgcn_sched_barrier(0); x49 -= l0.x * x0; x49 -= l0.y * x1; x49 -= l0.z * x2; x49 -= l0.w * x3; x49 -= l1.x * x4; x49 -= l1.y * x5; x49 -= l1.z * x6; x49 -= l1.w * x7; x49 -= l2.x * x8; x49 -= l2.y * x9; x49 -= l2.z * x10; x49 -= l2.w * x11; x49 -= l3.x * x12; x49 -= l3.y * x13; x49 -= l3.z * x14; x49 -= l3.w * x15; x49 -= l4.x * x16; x49 -= l4.y * x17; x49 -= l4.z * x18; x49 -= l4.w * x19; x49 -= l5.x * x20; x49 -= l5.y * x21; x49 -= l5.z * x22; x49 -= l5.w * x23; } __builtin_amdgcn_sched_barrier(0); { const v4f l6 = GDN_L4(49, 6); const v4f l7 = GDN_L4(49, 7); const v4f l8 = GDN_L4(49, 8); const v4f l9 = GDN_L4(49, 9); const v4f l10 = GDN_L4(49, 10); const v4f l11 = GDN_L4(49, 11); __builtin_amdgcn_sched_barrier(0); x49 -= l6.x * x24; x49 -= l6.y * x25; x49 -= l6.z * x26; x49 -= l6.w * x27; x49 -= l7.x * x28; x49 -= l7.y * x29; x49 -= l7.z * x30; x49 -= l7.w * x31; x49 -= l8.x * x32; x49 -= l8.y * x33; x49 -= l8.z * x34; x49 -= l8.w * x35; x49 -= l9.x * x36; x49 -= l9.y * x37; x49 -= l9.z * x38; x49 -= l9.w * x39; x49 -= l10.x * x40; x49 -= l10.y * x41; x49 -= l10.z * x42; x49 -= l10.w * x43; x49 -= l11.x * x44; x49 -= l11.y * x45; x49 -= l11.z * x46; x49 -= l11.w * x47; } __builtin_amdgcn_sched_barrier(0); { const v4f l12 = GDN_L4(49, 12); __builtin_amdgcn_sched_barrier(0); x49 -= l12.x * x48; } __builtin_amdgcn_sched_barrier(0);
        float x50 = GDN_RHS(50); { const v4f l0 = GDN_L4(50, 0); const v4f l1 = GDN_L4(50, 1); const v4f l2 = GDN_L4(50, 2); const v4f l3 = GDN_L4(50, 3); const v4f l4 = GDN_L4(50, 4); const v4f l5 = GDN_L4(50, 5); __builtin_amdgcn_sched_barrier(0); x50 -= l0.x * x0; x50 -= l0.y * x1; x50 -= l0.z * x2; x50 -= l0.w * x3; x50 -= l1.x * x4; x50 -= l1.y * x5; x50 -= l1.z * x6; x50 -= l1.w * x7; x50 -= l2.x * x8; x50 -= l2.y * x9; x50 -= l2.z * x10; x50 -= l2.w * x11; x50 -= l3.x * x12; x50 -= l3.y * x13; x50 -= l3.z * x14; x50 -= l3.w * x15; x50 -= l4.x * x16; x50 -= l4.y * x17; x50 -= l4.z * x18; x50 -= l4.w * x19; x50 -= l5.x * x20; x50 -= l5.y * x21; x50 -= l5.z * x22; x50 -= l5.w * x23; } __builtin_amdgcn_sched_barrier(0); { const v4f l6 = GDN_L4(50, 6); const v4f l7 = GDN_L4(50, 7); const v4f l8 = GDN_L4(50, 8); const v4f l9 = GDN_L4(50, 9); const v4f l10 = GDN_L4(50, 10); const v4f l11 = GDN_L4(50, 11); __builtin_amdgcn_sched_barrier(0); x50 -= l6.x * x24; x50 -= l6.y * x25; x50 -= l6.z * x26; x50 -= l6.w * x27; x50 -= l7.x * x28; x50 -= l7.y * x29; x50 -= l7.z * x30; x50 -= l7.w * x31; x50 -= l8.x * x32; x50 -= l8.y * x33; x50 -= l8.z * x34; x50 -= l8.w * x35; x50 -= l9.x * x36; x50 -= l9.y * x37; x50 -= l9.z * x38; x50 -= l9.w * x39; x50 -= l10.x * x40; x50 -= l10.y * x41; x50 -= l10.z * x42; x50 -= l10.w * x43; x50 -= l11.x * x44; x50 -= l11.y * x45; x50 -= l11.z * x46; x50 -= l11.w * x47; } __builtin_amdgcn_sched_barrier(0); { const v4f l12 = GDN_L4(50, 12); __builtin_amdgcn_sched_barrier(0); x50 -= l12.x * x48; x50 -= l12.y * x49; } __builtin_amdgcn_sched_barrier(0);
        float x51 = GDN_RHS(51); { const v4f l0 = GDN_L4(51, 0); const v4f l1 = GDN_L4(51, 1); const v4f l2 = GDN_L4(51, 2); const v4f l3 = GDN_L4(51, 3); const v4f l4 = GDN_L4(51, 4); const v4f l5 = GDN_L4(51, 5); __builtin_amdgcn_sched_barrier(0); x51 -= l0.x * x0; x51 -= l0.y * x1; x51 -= l0.z * x2; x51 -= l0.w * x3; x51 -= l1.x * x4; x51 -= l1.y * x5; x51 -= l1.z * x6; x51 -= l1.w * x7; x51 -= l2.x * x8; x51 -= l2.y * x9; x51 -= l2.z * x10; x51 -= l2.w * x11; x51 -= l3.x * x12; x51 -= l3.y * x13; x51 -= l3.z * x14; x51 -= l3.w * x15; x51 -= l4.x * x16; x51 -= l4.y * x17; x51 -= l4.z * x18; x51 -= l4.w * x19; x51 -= l5.x * x20; x51 -= l5.y * x21; x51 -= l5.z * x22; x51 -= l5.w * x23; } __builtin_amdgcn_sched_barrier(0); { const v4f l6 = GDN_L4(51, 6); const v4f l7 = GDN_L4(51, 7); const v4f l8 = GDN_L4(51, 8); const v4f l9 = GDN_L4(51, 9); const v4f l10 = GDN_L4(51, 10); const v4f l11 = GDN_L4(51, 11); __builtin_amdgcn_sched_barrier(0); x51 -= l6.x * x24; x51 -= l6.y * x25; x51 -= l6.z * x26; x51 -= l6.w * x27; x51 -= l7.x * x28; x51 -= l7.y * x29; x51 -= l7.z * x30; x51 -= l7.w * x31; x51 -= l8.x * x32; x51 -= l8.y * x33; x51 -= l8.z * x34; x51 -= l8.w * x35; x51 -= l9.x * x36; x51 -= l9.y * x37; x51 -= l9.z * x38; x51 -= l9.w * x39; x51 -= l10.x * x40; x51 -= l10.y * x41; x51 -= l10.z * x42; x51 -= l10.w * x43; x51 -= l11.x * x44; x51 -= l11.y * x45; x51 -= l11.z * x46; x51 -= l11.w * x47; } __builtin_amdgcn_sched_barrier(0); { const v4f l12 = GDN_L4(51, 12); __builtin_amdgcn_sched_barrier(0); x51 -= l12.x * x48; x51 -= l12.y * x49; x51 -= l12.z * x50; } __builtin_amdgcn_sched_barrier(0);
        float x52 = GDN_RHS(52); { const v4f l0 = GDN_L4(52, 0); const v4f l1 = GDN_L4(52, 1); const v4f l2 = GDN_L4(52, 2); const v4f l3 = GDN_L4(52, 3); const v4f l4 = GDN_L4(52, 4); const v4f l5 = GDN_L4(52, 5); __builtin_amdgcn_sched_barrier(0); x52 -= l0.x * x0; x52 -= l0.y * x1; x52 -= l0.z * x2; x52 -= l0.w * x3; x52 -= l1.x * x4; x52 -= l1.y * x5; x52 -= l1.z * x6; x52 -= l1.w * x7; x52 -= l2.x * x8; x52 -= l2.y * x9; x52 -= l2.z * x10; x52 -= l2.w * x11; x52 -= l3.x * x12; x52 -= l3.y * x13; x52 -= l3.z * x14; x52 -= l3.w * x15; x52 -= l4.x * x16; x52 -= l4.y * x17; x52 -= l4.z * x18; x52 -= l4.w * x19; x52 -= l5.x * x20; x52 -= l5.y * x21; x52 -= l5.z * x22; x52 -= l5.w * x23; } __builtin_amdgcn_sched_barrier(0); { const v4f l6 = GDN_L4(52, 6); const v4f l7 = GDN_L4(52, 7); const v4f l8 = GDN_L4(52, 8); const v4f l9 = GDN_L4(52, 9); const v4f l10 = GDN_L4(52, 10); const v4f l11 = GDN_L4(52, 11); __builtin_amdgcn_sched_barrier(0); x52 -= l6.x * x24; x52 -= l6.y * x25; x52 -= l6.z * x26; x52 -= l6.w * x27; x52 -= l7.x * x28; x52 -= l7.y * x29; x52 -= l7.z * x30; x52 -= l7.w * x31; x52 -= l8.x * x32; x52 -= l8.y * x33; x52 -= l8.z * x34; x52 -= l8.w * x35; x52 -= l9.x * x36; x52 -= l9.y * x37; x52 -= l9.z * x38; x52 -= l9.w * x39; x52 -= l10.x * x40; x52 -= l10.y * x41; x52 -= l10.z * x42; x52 -= l10.w * x43; x52 -= l11.x * x44; x52 -= l11.y * x45; x52 -= l11.z * x46; x52 -= l11.w * x47; } __builtin_amdgcn_sched_barrier(0); { const v4f l12 = GDN_L4(52, 12); __builtin_amdgcn_sched_barrier(0); x52 -= l12.x * x48; x52 -= l12.y * x49; x52 -= l12.z * x50; x52 -= l12.w * x51; } __builtin_amdgcn_sched_barrier(0);
        float x53 = GDN_RHS(53); { const v4f l0 = GDN_L4(53, 0); const v4f l1 = GDN_L4(53, 1); const v4f l2 = GDN_L4(53, 2); const v4f l3 = GDN_L4(53, 3); const v4f l4 = GDN_L4(53, 4); const v4f l5 = GDN_L4(53, 5); __builtin_amdgcn_sched_barrier(0); x53 -= l0.x * x0; x53 -= l0.y * x1; x53 -= l0.z * x2; x53 -= l0.w * x3; x53 -= l1.x * x4; x53 -= l1.y * x5; x53 -= l1.z * x6; x53 -= l1.w * x7; x53 -= l2.x * x8; x53 -= l2.y * x9; x53 -= l2.z * x10; x53 -= l2.w * x11; x53 -= l3.x * x12; x53 -= l3.y * x13; x53 -= l3.z * x14; x53 -= l3.w * x15; x53 -= l4.x * x16; x53 -= l4.y * x17; x53 -= l4.z * x18; x53 -= l4.w * x19; x53 -= l5.x * x20; x53 -= l5.y * x21; x53 -= l5.z * x22; x53 -= l5.w * x23; } __builtin_amdgcn_sched_barrier(0); { const v4f l6 = GDN_L4(53, 6); const v4f l7 = GDN_L4(53, 7); const v4f l8 = GDN_L4(53, 8); const v4f l9 = GDN_L4(53, 9); const v4f l10 = GDN_L4(53, 10); const v4f l11 = GDN_L4(53, 11); __builtin_amdgcn_sched_barrier(0); x53 -= l6.x * x24; x53 -= l6.y * x25; x53 -= l6.z * x26; x53 -= l6.w * x27; x53 -= l7.x * x28; x53 -= l7.y * x29; x53 -= l7.z * x30; x53 -= l7.w * x31; x53 -= l8.x * x32; x53 -= l8.y * x33; x53 -= l8.z * x34; x53 -= l8.w * x35; x53 -= l9.x * x36; x53 -= l9.y * x37; x53 -= l9.z * x38; x53 -= l9.w * x39; x53 -= l10.x * x40; x53 -= l10.y * x41; x53 -= l10.z * x42; x53 -= l10.w * x43; x53 -= l11.x * x44; x53 -= l11.y * x45; x53 -= l11.z * x46; x53 -= l11.w * x47; } __builtin_amdgcn_sched_barrier(0); { const v4f l12 = GDN_L4(53, 12); const v4f l13 = GDN_L4(53, 13); __builtin_amdgcn_sched_barrier(0); x53 -= l12.x * x48; x53 -= l12.y * x49; x53 -= l12.z * x50; x53 -= l12.w * x51; x53 -= l13.x * x52; } __builtin_amdgcn_sched_barrier(0);
        float x54 = GDN_RHS(54); { const v4f l0 = GDN_L4(54, 0); const v4f l1 = GDN_L4(54, 1); const v4f l2 = GDN_L4(54, 2); const v4f l3 = GDN_L4(54, 3); const v4f l4 = GDN_L4(54, 4); const v4f l5 = GDN_L4(54, 5); __builtin_amdgcn_sched_barrier(0); x54 -= l0.x * x0; x54 -= l0.y * x1; x54 -= l0.z * x2; x54 -= l0.w * x3; x54 -= l1.x * x4; x54 -= l1.y * x5; x54 -= l1.z * x6; x54 -= l1.w * x7; x54 -= l2.x * x8; x54 -= l2.y * x9; x54 -= l2.z * x10; x54 -= l2.w * x11; x54 -= l3.x * x12; x54 -= l3.y * x13; x54 -= l3.z * x14; x54 -= l3.w * x15; x54 -= l4.x * x16; x54 -= l4.y * x17; x54 -= l4.z * x18; x54 -= l4.w * x19; x54 -= l5.x * x20; x54 -= l5.y * x21; x54 -= l5.z * x22; x54 -= l5.w * x23; } __builtin_amdgcn_sched_barrier(0); { const v4f l6 = GDN_L4(54, 6); const v4f l7 = GDN_L4(54, 7); const v4f l8 = GDN_L4(54, 8); const v4f l9 = GDN_L4(54, 9); const v4f l10 = GDN_L4(54, 10); const v4f l11 = GDN_L4(54, 11); __builtin_amdgcn_sched_barrier(0); x54 -= l6.x * x24; x54 -= l6.y * x25; x54 -= l6.z * x26; x54 -= l6.w * x27; x54 -= l7.x * x28; x54 -= l7.y * x29; x54 -= l7.z * x30; x54 -= l7.w * x31; x54 -= l8.x * x32; x54 -= l8.y * x33; x54 -= l8.z * x34; x54 -= l8.w * x35; x54 -= l9.x * x36; x54 -= l9.y * x37; x54 -= l9.z * x38; x54 -= l9.w * x39; x54 -= l10.x * x40; x54 -= l10.y * x41; x54 -= l10.z * x42; x54 -= l10.w * x43; x54 -= l11.x * x44; x54 -= l11.y * x45; x54 -= l11.z * x46; x54 -= l11.w * x47; } __builtin_amdgcn_sched_barrier(0); { const v4f l12 = GDN_L4(54, 12); const v4f l13 = GDN_L4(54, 13); __builtin_amdgcn_sched_barrier(0); x54 -= l12.x * x48; x54 -= l12.y * x49; x54 -= l12.z * x50; x54 -= l12.w * x51; x54 -= l13.x * x52; x54 -= l13.y * x53; } __builtin_amdgcn_sched_barrier(0);
        float x55 = GDN_RHS(55); { const v4f l0 = GDN_L4(55, 0); const v4f l1 = GDN_L4(55, 1); const v4f l2 = GDN_L4(55, 2); const v4f l3 = GDN_L4(55, 3); const v4f l4 = GDN_L4(55, 4); const v4f l5 = GDN_L4(55, 5); __builtin_amdgcn_sched_barrier(0); x55 -= l0.x * x0; x55 -= l0.y * x1; x55 -= l0.z * x2; x55 -= l0.w * x3; x55 -= l1.x * x4; x55 -= l1.y * x5; x55 -= l1.z * x6; x55 -= l1.w * x7; x55 -= l2.x * x8; x55 -= l2.y * x9; x55 -= l2.z * x10; x55 -= l2.w * x11; x55 -= l3.x * x12; x55 -= l3.y * x13; x55 -= l3.z * x14; x55 -= l3.w * x15; x55 -= l4.x * x16; x55 -= l4.y * x17; x55 -= l4.z * x18; x55 -= l4.w * x19; x55 -= l5.x * x20; x55 -= l5.y * x21; x55 -= l5.z * x22; x55 -= l5.w * x23; } __builtin_amdgcn_sched_barrier(0); { const v4f l6 = GDN_L4(55, 6); const v4f l7 = GDN_L4(55, 7); const v4f l8 = GDN_L4(55, 8); const v4f l9 = GDN_L4(55, 9); const v4f l10 = GDN_L4(55, 10); const v4f l11 = GDN_L4(55, 11); __builtin_amdgcn_sched_barrier(0); x55 -= l6.x * x24; x55 -= l6.y * x25; x55 -= l6.z * x26; x55 -= l6.w * x27; x55 -= l7.x * x28; x55 -= l7.y * x29; x55 -= l7.z * x30; x55 -= l7.w * x31; x55 -= l8.x * x32; x55 -= l8.y * x33; x55 -= l8.z * x34; x55 -= l8.w * x35; x55 -= l9.x * x36; x55 -= l9.y * x37; x55 -= l9.z * x38; x55 -= l9.w * x39; x55 -= l10.x * x40; x55 -= l10.y * x41; x55 -= l10.z * x42; x55 -= l10.w * x43; x55 -= l11.x * x44; x55 -= l11.y * x45; x55 -= l11.z * x46; x55 -= l11.w * x47; } __builtin_amdgcn_sched_barrier(0); { const v4f l12 = GDN_L4(55, 12); const v4f l13 = GDN_L4(55, 13); __builtin_amdgcn_sched_barrier(0); x55 -= l12.x * x48; x55 -= l12.y * x49; x55 -= l12.z * x50; x55 -= l12.w * x51; x55 -= l13.x * x52; x55 -= l13.y * x53; x55 -= l13.z * x54; } __builtin_amdgcn_sched_barrier(0);
        float x56 = GDN_RHS(56); { const v4f l0 = GDN_L4(56, 0); const v4f l1 = GDN_L4(56, 1); const v4f l2 = GDN_L4(56, 2); const v4f l3 = GDN_L4(56, 3); const v4f l4 = GDN_L4(56, 4); const v4f l5 = GDN_L4(56, 5); __builtin_amdgcn_sched_barrier(0); x56 -= l0.x * x0; x56 -= l0.y * x1; x56 -= l0.z * x2; x56 -= l0.w * x3; x56 -= l1.x * x4; x56 -= l1.y * x5; x56 -= l1.z * x6; x56 -= l1.w * x7; x56 -= l2.x * x8; x56 -= l2.y * x9; x56 -= l2.z * x10; x56 -= l2.w * x11; x56 -= l3.x * x12; x56 -= l3.y * x13; x56 -= l3.z * x14; x56 -= l3.w * x15; x56 -= l4.x * x16; x56 -= l4.y * x17; x56 -= l4.z * x18; x56 -= l4.w * x19; x56 -= l5.x * x20; x56 -= l5.y * x21; x56 -= l5.z * x22; x56 -= l5.w * x23; } __builtin_amdgcn_sched_barrier(0); { const v4f l6 = GDN_L4(56, 6); const v4f l7 = GDN_L4(56, 7); const v4f l8 = GDN_L4(56, 8); const v4f l9 = GDN_L4(56, 9); const v4f l10 = GDN_L4(56, 10); const v4f l11 = GDN_L4(56, 11); __builtin_amdgcn_sched_barrier(0); x56 -= l6.x * x24; x56 -= l6.y * x25; x56 -= l6.z * x26; x56 -= l6.w * x27; x56 -= l7.x * x28; x56 -= l7.y * x29; x56 -= l7.z * x30; x56 -= l7.w * x31; x56 -= l8.x * x32; x56 -= l8.y * x33; x56 -= l8.z * x34; x56 -= l8.w * x35; x56 -= l9.x * x36; x56 -= l9.y * x37; x56 -= l9.z * x38; x56 -= l9.w * x39; x56 -= l10.x * x40; x56 -= l10.y * x41; x56 -= l10.z * x42; x56 -= l10.w * x43; x56 -= l11.x * x44; x56 -= l11.y * x45; x56 -= l11.z * x46; x56 -= l11.w * x47; } __builtin_amdgcn_sched_barrier(0); { const v4f l12 = GDN_L4(56, 12); const v4f l13 = GDN_L4(56, 13); __builtin_amdgcn_sched_barrier(0); x56 -= l12.x * x48; x56 -= l12.y * x49; x56 -= l12.z * x50; x56 -= l12.w * x51; x56 -= l13.x * x52; x56 -= l13.y * x53; x56 -= l13.z * x54; x56 -= l13.w * x55; } __builtin_amdgcn_sched_barrier(0);
        float x57 = GDN_RHS(57); { const v4f l0 = GDN_L4(57, 0); const v4f l1 = GDN_L4(57, 1); const v4f l2 = GDN_L4(57, 2); const v4f l3 = GDN_L4(57, 3); const v4f l4 = GDN_L4(57, 4); const v4f l5 = GDN_L4(57, 5); __builtin_amdgcn_sched_barrier(0); x57 -= l0.x * x0; x57 -= l0.y * x1; x57 -= l0.z * x2; x57 -= l0.w * x3; x57 -= l1.x * x4; x57 -= l1.y * x5; x57 -= l1.z * x6; x57 -= l1.w * x7; x57 -= l2.x * x8; x57 -= l2.y * x9; x57 -= l2.z * x10; x57 -= l2.w * x11; x57 -= l3.x * x12; x57 -= l3.y * x13; x57 -= l3.z * x14; x57 -= l3.w * x15; x57 -= l4.x * x16; x57 -= l4.y * x17; x57 -= l4.z * x18; x57 -= l4.w * x19; x57 -= l5.x * x20; x57 -= l5.y * x21; x57 -= l5.z * x22; x57 -= l5.w * x23; } __builtin_amdgcn_sched_barrier(0); { const v4f l6 = GDN_L4(57, 6); const v4f l7 = GDN_L4(57, 7); const v4f l8 = GDN_L4(57, 8); const v4f l9 = GDN_L4(57, 9); const v4f l10 = GDN_L4(57, 10); const v4f l11 = GDN_L4(57, 11); __builtin_amdgcn_sched_barrier(0); x57 -= l6.x * x24; x57 -= l6.y * x25; x57 -= l6.z * x26; x57 -= l6.w * x27; x57 -= l7.x * x28; x57 -= l7.y * x29; x57 -= l7.z * x30; x57 -= l7.w * x31; x57 -= l8.x * x32; x57 -= l8.y * x33; x57 -= l8.z * x34; x57 -= l8.w * x35; x57 -= l9.x * x36; x57 -= l9.y * x37; x57 -= l9.z * x38; x57 -= l9.w * x39; x57 -= l10.x * x40; x57 -= l10.y * x41; x57 -= l10.z * x42; x57 -= l10.w * x43; x57 -= l11.x * x44; x57 -= l11.y * x45; x57 -= l11.z * x46; x57 -= l11.w * x47; } __builtin_amdgcn_sched_barrier(0); { const v4f l12 = GDN_L4(57, 12); const v4f l13 = GDN_L4(57, 13); const v4f l14 = GDN_L4(57, 14); __builtin_amdgcn_sched_barrier(0); x57 -= l12.x * x48; x57 -= l12.y * x49; x57 -= l12.z * x50; x57 -= l12.w * x51; x57 -= l13.x * x52; x57 -= l13.y * x53; x57 -= l13.z * x54; x57 -= l13.w * x55; x57 -= l14.x * x56; } __builtin_amdgcn_sched_barrier(0);
        float x58 = GDN_RHS(58); { const v4f l0 = GDN_L4(58, 0); const v4f l1 = GDN_L4(58, 1); const v4f l2 = GDN_L4(58, 2); const v4f l3 = GDN_L4(58, 3); const v4f l4 = GDN_L4(58, 4); const v4f l5 = GDN_L4(58, 5); __builtin_amdgcn_sched_barrier(0); x58 -= l0.x * x0; x58 -= l0.y * x1; x58 -= l0.z * x2; x58 -= l0.w * x3; x58 -= l1.x * x4; x58 -= l1.y * x5; x58 -= l1.z * x6; x58 -= l1.w * x7; x58 -= l2.x * x8; x58 -= l2.y * x9; x58 -= l2.z * x10; x58 -= l2.w * x11; x58 -= l3.x * x12; x58 -= l3.y * x13; x58 -= l3.z * x14; x58 -= l3.w * x15; x58 -= l4.x * x16; x58 -= l4.y * x17; x58 -= l4.z * x18; x58 -= l4.w * x19; x58 -= l5.x * x20; x58 -= l5.y * x21; x58 -= l5.z * x22; x58 -= l5.w * x23; } __builtin_amdgcn_sched_barrier(0); { const v4f l6 = GDN_L4(58, 6); const v4f l7 = GDN_L4(58, 7); const v4f l8 = GDN_L4(58, 8); const v4f l9 = GDN_L4(58, 9); const v4f l10 = GDN_L4(58, 10); const v4f l11 = GDN_L4(58, 11); __builtin_amdgcn_sched_barrier(0); x58 -= l6.x * x24; x58 -= l6.y * x25; x58 -= l6.z * x26; x58 -= l6.w * x27; x58 -= l7.x * x28; x58 -= l7.y * x29; x58 -= l7.z * x30; x58 -= l7.w * x31; x58 -= l8.x * x32; x58 -= l8.y * x33; x58 -= l8.z * x34; x58 -= l8.w * x35; x58 -= l9.x * x36; x58 -= l9.y * x37; x58 -= l9.z * x38; x58 -= l9.w * x39; x58 -= l10.x * x40; x58 -= l10.y * x41; x58 -= l10.z * x42; x58 -= l10.w * x43; x58 -= l11.x * x44; x58 -= l11.y * x45; x58 -= l11.z * x46; x58 -= l11.w * x47; } __builtin_amdgcn_sched_barrier(0); { const v4f l12 = GDN_L4(58, 12); const v4f l13 = GDN_L4(58, 13); const v4f l14 = GDN_L4(58, 14); __builtin_amdgcn_sched_barrier(0); x58 -= l12.x * x48; x58 -= l12.y * x49; x58 -= l12.z * x50; x58 -= l12.w * x51; x58 -= l13.x * x52; x58 -= l13.y * x53; x58 -= l13.z * x54; x58 -= l13.w * x55; x58 -= l14.x * x56; x58 -= l14.y * x57; } __builtin_amdgcn_sched_barrier(0);
        float x59 = GDN_RHS(59); { const v4f l0 = GDN_L4(59, 0); const v4f l1 = GDN_L4(59, 1); const v4f l2 = GDN_L4(59, 2); const v4f l3 = GDN_L4(59, 3); const v4f l4 = GDN_L4(59, 4); const v4f l5 = GDN_L4(59, 5); __builtin_amdgcn_sched_barrier(0); x59 -= l0.x * x0; x59 -= l0.y * x1; x59 -= l0.z * x2; x59 -= l0.w * x3; x59 -= l1.x * x4; x59 -= l1.y * x5; x59 -= l1.z * x6; x59 -= l1.w * x7; x59 -= l2.x * x8; x59 -= l2.y * x9; x59 -= l2.z * x10; x59 -= l2.w * x11; x59 -= l3.x * x12; x59 -= l3.y * x13; x59 -= l3.z * x14; x59 -= l3.w * x15; x59 -= l4.x * x16; x59 -= l4.y * x17; x59 -= l4.z * x18; x59 -= l4.w * x19; x59 -= l5.x * x20; x59 -= l5.y * x21; x59 -= l5.z * x22; x59 -= l5.w * x23; } __builtin_amdgcn_sched_barrier(0); { const v4f l6 = GDN_L4(59, 6); const v4f l7 = GDN_L4(59, 7); const v4f l8 = GDN_L4(59, 8); const v4f l9 = GDN_L4(59, 9); const v4f l10 = GDN_L4(59, 10); const v4f l11 = GDN_L4(59, 11); __builtin_amdgcn_sched_barrier(0); x59 -= l6.x * x24; x59 -= l6.y * x25; x59 -= l6.z * x26; x59 -= l6.w * x27; x59 -= l7.x * x28; x59 -= l7.y * x29; x59 -= l7.z * x30; x59 -= l7.w * x31; x59 -= l8.x * x32; x59 -= l8.y * x33; x59 -= l8.z * x34; x59 -= l8.w * x35; x59 -= l9.x * x36; x59 -= l9.y * x37; x59 -= l9.z * x38; x59 -= l9.w * x39; x59 -= l10.x * x40; x59 -= l10.y * x41; x59 -= l10.z * x42; x59 -= l10.w * x43; x59 -= l11.x * x44; x59 -= l11.y * x45; x59 -= l11.z * x46; x59 -= l11.w * x47; } __builtin_amdgcn_sched_barrier(0); { const v4f l12 = GDN_L4(59, 12); const v4f l13 = GDN_L4(59, 13); const v4f l14 = GDN_L4(59, 14); __builtin_amdgcn_sched_barrier(0); x59 -= l12.x * x48; x59 -= l12.y * x49; x59 -= l12.z * x50; x59 -= l12.w * x51; x59 -= l13.x * x52; x59 -= l13.y * x53; x59 -= l13.z * x54; x59 -= l13.w * x55; x59 -= l14.x * x56; x59 -= l14.y * x57; x59 -= l14.z * x58; } __builtin_amdgcn_sched_barrier(0);
        float x60 = GDN_RHS(60); { const v4f l0 = GDN_L4(60, 0); const v4f l1 = GDN_L4(60, 1); const v4f l2 = GDN_L4(60, 2); const v4f l3 = GDN_L4(60, 3); const v4f l4 = GDN_L4(60, 4); const v4f l5 = GDN_L4(60, 5); __builtin_amdgcn_sched_barrier(0); x60 -= l0.x * x0; x60 -= l0.y * x1; x60 -= l0.z * x2; x60 -= l0.w * x3; x60 -= l1.x * x4; x60 -= l1.y * x5; x60 -= l1.z * x6; x60 -= l1.w * x7; x60 -= l2.x * x8; x60 -= l2.y * x9; x60 -= l2.z * x10; x60 -= l2.w * x11; x60 -= l3.x * x12; x60 -= l3.y * x13; x60 -= l3.z * x14; x60 -= l3.w * x15; x60 -= l4.x * x16; x60 -= l4.y * x17; x60 -= l4.z * x18; x60 -= l4.w * x19; x60 -= l5.x * x20; x60 -= l5.y * x21; x60 -= l5.z * x22; x60 -= l5.w * x23; } __builtin_amdgcn_sched_barrier(0); { const v4f l6 = GDN_L4(60, 6); const v4f l7 = GDN_L4(60, 7); const v4f l8 = GDN_L4(60, 8); const v4f l9 = GDN_L4(60, 9); const v4f l10 = GDN_L4(60, 10); const v4f l11 = GDN_L4(60, 11); __builtin_amdgcn_sched_barrier(0); x60 -= l6.x * x24; x60 -= l6.y * x25; x60 -= l6.z * x26; x60 -= l6.w * x27; x60 -= l7.x * x28; x60 -= l7.y * x29; x60 -= l7.z * x30; x60 -= l7.w * x31; x60 -= l8.x * x32; x60 -= l8.y * x33; x60 -= l8.z * x34; x60 -= l8.w * x35; x60 -= l9.x * x36; x60 -= l9.y * x37; x60 -= l9.z * x38; x60 -= l9.w * x39; x60 -= l10.x * x40; x60 -= l10.y * x41; x60 -= l10.z * x42; x60 -= l10.w * x43; x60 -= l11.x * x44; x60 -= l11.y * x45; x60 -= l11.z * x46; x60 -= l11.w * x47; } __builtin_amdgcn_sched_barrier(0); { const v4f l12 = GDN_L4(60, 12); const v4f l13 = GDN_L4(60, 13); const v4f l14 = GDN_L4(60, 14); __builtin_amdgcn_sched_barrier(0); x60 -= l12.x * x48; x60 -= l12.y * x49; x60 -= l12.z * x50; x60 -= l12.w * x51; x60 -= l13.x * x52; x60 -= l13.y * x53; x60 -= l13.z * x54; x60 -= l13.w * x55; x60 -= l14.x * x56; x60 -= l14.y * x57; x60 -= l14.z * x58; x60 -= l14.w * x59; } __builtin_amdgcn_sched_barrier(0);
        float x61 = GDN_RHS(61); { const v4f l0 = GDN_L4(61, 0); const v4f l1 = GDN_L4(61, 1); const v4f l2 = GDN_L4(61, 2); const v4f l3 = GDN_L4(61, 3); const v4f l4 = GDN_L4(61, 4); const v4f l5 = GDN_L4(61, 5); __builtin_amdgcn_sched_barrier(0); x61 -= l0.x * x0; x61 -= l0.y * x1; x61 -= l0.z * x2; x61 -= l0.w * x3; x61 -= l1.x * x4; x61 -= l1.y * x5; x61 -= l1.z * x6; x61 -= l1.w * x7; x61 -= l2.x * x8; x61 -= l2.y * x9; x61 -= l2.z * x10; x61 -= l2.w * x11; x61 -= l3.x * x12; x61 -= l3.y * x13; x61 -= l3.z * x14; x61 -= l3.w * x15; x61 -= l4.x * x16; x61 -= l4.y * x17; x61 -= l4.z * x18; x61 -= l4.w * x19; x61 -= l5.x * x20; x61 -= l5.y * x21; x61 -= l5.z * x22; x61 -= l5.w * x23; } __builtin_amdgcn_sched_barrier(0); { const v4f l6 = GDN_L4(61, 6); const v4f l7 = GDN_L4(61, 7); const v4f l8 = GDN_L4(61, 8); const v4f l9 = GDN_L4(61, 9); const v4f l10 = GDN_L4(61, 10); const v4f l11 = GDN_L4(61, 11); __builtin_amdgcn_sched_barrier(0); x61 -= l6.x * x24; x61 -= l6.y * x25; x61 -= l6.z * x26; x61 -= l6.w * x27; x61 -= l7.x * x28; x61 -= l7.y * x29; x61 -= l7.z * x30; x61 -= l7.w * x31; x61 -= l8.x * x32; x61 -= l8.y * x33; x61 -= l8.z * x34; x61 -= l8.w * x35; x61 -= l9.x * x36; x61 -= l9.y * x37; x61 -= l9.z * x38; x61 -= l9.w * x39; x61 -= l10.x * x40; x61 -= l10.y * x41; x61 -= l10.z * x42; x61 -= l10.w * x43; x61 -= l11.x * x44; x61 -= l11.y * x45; x61 -= l11.z * x46; x61 -= l11.w * x47; } __builtin_amdgcn_sched_barrier(0); { const v4f l12 = GDN_L4(61, 12); const v4f l13 = GDN_L4(61, 13); const v4f l14 = GDN_L4(61, 14); const v4f l15 = GDN_L4(61, 15); __builtin_amdgcn_sched_barrier(0); x61 -= l12.x * x48; x61 -= l12.y * x49; x61 -= l12.z * x50; x61 -= l12.w * x51; x61 -= l13.x * x52; x61 -= l13.y * x53; x61 -= l13.z * x54; x61 -= l13.w * x55; x61 -= l14.x * x56; x61 -= l14.y * x57; x61 -= l14.z * x58; x61 -= l14.w * x59; x61 -= l15.x * x60; } __builtin_amdgcn_sched_barrier(0);
        float x62 = GDN_RHS(62); { const v4f l0 = GDN_L4(62, 0); const v4f l1 = GDN_L4(62, 1); const v4f l2 = GDN_L4(62, 2); const v4f l3 = GDN_L4(62, 3); const v4f l4 = GDN_L4(62, 4); const v4f l5 = GDN_L4(62, 5); __builtin_amdgcn_sched_barrier(0); x62 -= l0.x * x0; x62 -= l0.y * x1; x62 -= l0.z * x2; x62 -= l0.w * x3; x62 -= l1.x * x4; x62 -= l1.y * x5; x62 -= l1.z * x6; x62 -= l1.w * x7; x62 -= l2.x * x8; x62 -= l2.y * x9; x62 -= l2.z * x10; x62 -= l2.w * x11; x62 -= l3.x * x12; x62 -= l3.y * x13; x62 -= l3.z * x14; x62 -= l3.w * x15; x62 -= l4.x * x16; x62 -= l4.y * x17; x62 -= l4.z * x18; x62 -= l4.w * x19; x62 -= l5.x * x20; x62 -= l5.y * x21; x62 -= l5.z * x22; x62 -= l5.w * x23; } __builtin_amdgcn_sched_barrier(0); { const v4f l6 = GDN_L4(62, 6); const v4f l7 = GDN_L4(62, 7); const v4f l8 = GDN_L4(62, 8); const v4f l9 = GDN_L4(62, 9); const v4f l10 = GDN_L4(62, 10); const v4f l11 = GDN_L4(62, 11); __builtin_amdgcn_sched_barrier(0); x62 -= l6.x * x24; x62 -= l6.y * x25; x62 -= l6.z * x26; x62 -= l6.w * x27; x62 -= l7.x * x28; x62 -= l7.y * x29; x62 -= l7.z * x30; x62 -= l7.w * x31; x62 -= l8.x * x32; x62 -= l8.y * x33; x62 -= l8.z * x34; x62 -= l8.w * x35; x62 -= l9.x * x36; x62 -= l9.y * x37; x62 -= l9.z * x38; x62 -= l9.w * x39; x62 -= l10.x * x40; x62 -= l10.y * x41; x62 -= l10.z * x42; x62 -= l10.w * x43; x62 -= l11.x * x44; x62 -= l11.y * x45; x62 -= l11.z * x46; x62 -= l11.w * x47; } __builtin_amdgcn_sched_barrier(0); { const v4f l12 = GDN_L4(62, 12); const v4f l13 = GDN_L4(62, 13); const v4f l14 = GDN_L4(62, 14); const v4f l15 = GDN_L4(62, 15); __builtin_amdgcn_sched_barrier(0); x62 -= l12.x * x48; x62 -= l12.y * x49; x62 -= l12.z * x50; x62 -= l12.w * x51; x62 -= l13.x * x52; x62 -= l13.y * x53; x62 -= l13.z * x54; x62 -= l13.w * x55; x62 -= l14.x * x56; x62 -= l14.y * x57; x62 -= l14.z * x58; x62 -= l14.w * x59; x62 -= l15.x * x60; x62 -= l15.y * x61; } __builtin_amdgcn_sched_barrier(0);
        float x63 = GDN_RHS(63); { const v4f l0 = GDN_L4(63, 0); const v4f l1 = GDN_L4(63, 1); const v4f l2 = GDN_L4(63, 2); const v4f l3 = GDN_L4(63, 3); const v4f l4 = GDN_L4(63, 4); const v4f l5 = GDN_L4(63, 5); __builtin_amdgcn_sched_barrier(0); x63 -= l0.x * x0; x63 -= l0.y * x1; x63 -= l0.z * x2; x63 -= l0.w * x3; x63 -= l1.x * x4; x63 -= l1.y * x5; x63 -= l1.z * x6; x63 -= l1.w * x7; x63 -= l2.x * x8; x63 -= l2.y * x9; x63 -= l2.z * x10; x63 -= l2.w * x11; x63 -= l3.x * x12; x63 -= l3.y * x13; x63 -= l3.z * x14; x63 -= l3.w * x15; x63 -= l4.x * x16; x63 -= l4.y * x17; x63 -= l4.z * x18; x63 -= l4.w * x19; x63 -= l5.x * x20; x63 -= l5.y * x21; x63 -= l5.z * x22; x63 -= l5.w * x23; } __builtin_amdgcn_sched_barrier(0); { const v4f l6 = GDN_L4(63, 6); const v4f l7 = GDN_L4(63, 7); const v4f l8 = GDN_L4(63, 8); const v4f l9 = GDN_L4(63, 9); const v4f l10 = GDN_L4(63, 10); const v4f l11 = GDN_L4(63, 11); __builtin_amdgcn_sched_barrier(0); x63 -= l6.x * x24; x63 -= l6.y * x25; x63 -= l6.z * x26; x63 -= l6.w * x27; x63 -= l7.x * x28; x63 -= l7.y * x29; x63 -= l7.z * x30; x63 -= l7.w * x31; x63 -= l8.x * x32; x63 -= l8.y * x33; x63 -= l8.z * x34; x63 -= l8.w * x35; x63 -= l9.x * x36; x63 -= l9.y * x37; x63 -= l9.z * x38; x63 -= l9.w * x39; x63 -= l10.x * x40; x63 -= l10.y * x41; x63 -= l10.z * x42; x63 -= l10.w * x43; x63 -= l11.x * x44; x63 -= l11.y * x45; x63 -= l11.z * x46; x63 -= l11.w * x47; } __builtin_amdgcn_sched_barrier(0); { const v4f l12 = GDN_L4(63, 12); const v4f l13 = GDN_L4(63, 13); const v4f l14 = GDN_L4(63, 14); const v4f l15 = GDN_L4(63, 15); __builtin_amdgcn_sched_barrier(0); x63 -= l12.x * x48; x63 -= l12.y * x49; x63 -= l12.z * x50; x63 -= l12.w * x51; x63 -= l13.x * x52; x63 -= l13.y * x53; x63 -= l13.z * x54; x63 -= l13.w * x55; x63 -= l14.x * x56; x63 -= l14.y * x57; x63 -= l14.z * x58; x63 -= l14.w * x59; x63 -= l15.x * x60; x63 -= l15.y * x61; x63 -= l15.z * x62; } __builtin_amdgcn_sched_barrier(0);
        if (c < 128) { GU[0 * 128 + c] = x0; GU[1 * 128 + c] = x1; GU[2 * 128 + c] = x2; GU[3 * 128 + c] = x3; GU[4 * 128 + c] = x4; GU[5 * 128 + c] = x5; GU[6 * 128 + c] = x6; GU[7 * 128 + c] = x7; GU[8 * 128 + c] = x8; GU[9 * 128 + c] = x9; GU[10 * 128 + c] = x10; GU[11 * 128 + c] = x11; GU[12 * 128 + c] = x12; GU[13 * 128 + c] = x13; GU[14 * 128 + c] = x14; GU[15 * 128 + c] = x15; GU[16 * 128 + c] = x16; GU[17 * 128 + c] = x17; GU[18 * 128 + c] = x18; GU[19 * 128 + c] = x19; GU[20 * 128 + c] = x20; GU[21 * 128 + c] = x21; GU[22 * 128 + c] = x22; GU[23 * 128 + c] = x23; GU[24 * 128 + c] = x24; GU[25 * 128 + c] = x25; GU[26 * 128 + c] = x26; GU[27 * 128 + c] = x27; GU[28 * 128 + c] = x28; GU[29 * 128 + c] = x29; GU[30 * 128 + c] = x30; GU[31 * 128 + c] = x31; GU[32 * 128 + c] = x32; GU[33 * 128 + c] = x33; GU[34 * 128 + c] = x34; GU[35 * 128 + c] = x35; GU[36 * 128 + c] = x36; GU[37 * 128 + c] = x37; GU[38 * 128 + c] = x38; GU[39 * 128 + c] = x39; GU[40 * 128 + c] = x40; GU[41 * 128 + c] = x41; GU[42 * 128 + c] = x42; GU[43 * 128 + c] = x43; GU[44 * 128 + c] = x44; GU[45 * 128 + c] = x45; GU[46 * 128 + c] = x46; GU[47 * 128 + c] = x47; GU[48 * 128 + c] = x48; GU[49 * 128 + c] = x49; GU[50 * 128 + c] = x50; GU[51 * 128 + c] = x51; GU[52 * 128 + c] = x52; GU[53 * 128 + c] = x53; GU[54 * 128 + c] = x54; GU[55 * 128 + c] = x55; GU[56 * 128 + c] = x56; GU[57 * 128 + c] = x57; GU[58 * 128 + c] = x58; GU[59 * 128 + c] = x59; GU[60 * 128 + c] = x60; GU[61 * 128 + c] = x61; GU[62 * 128 + c] = x62; GU[63 * 128 + c] = x63; }
        else { GNW[0 * 128 + (c - 128)] = (bf16)f2bf(-x0); GNW[1 * 128 + (c - 128)] = (bf16)f2bf(-x1); GNW[2 * 128 + (c - 128)] = (bf16)f2bf(-x2); GNW[3 * 128 + (c - 128)] = (bf16)f2bf(-x3); GNW[4 * 128 + (c - 128)] = (bf16)f2bf(-x4); GNW[5 * 128 + (c - 128)] = (bf16)f2bf(-x5); GNW[6 * 128 + (c - 128)] = (bf16)f2bf(-x6); GNW[7 * 128 + (c - 128)] = (bf16)f2bf(-x7); GNW[8 * 128 + (c - 128)] = (bf16)f2bf(-x8); GNW[9 * 128 + (c - 128)] = (bf16)f2bf(-x9); GNW[10 * 128 + (c - 128)] = (bf16)f2bf(-x10); GNW[11 * 128 + (c - 128)] = (bf16)f2bf(-x11); GNW[12 * 128 + (c - 128)] = (bf16)f2bf(-x12); GNW[13 * 128 + (c - 128)] = (bf16)f2bf(-x13); GNW[14 * 128 + (c - 128)] = (bf16)f2bf(-x14); GNW[15 * 128 + (c - 128)] = (bf16)f2bf(-x15); GNW[16 * 128 + (c - 128)] = (bf16)f2bf(-x16); GNW[17 * 128 + (c - 128)] = (bf16)f2bf(-x17); GNW[18 * 128 + (c - 128)] = (bf16)f2bf(-x18); GNW[19 * 128 + (c - 128)] = (bf16)f2bf(-x19); GNW[20 * 128 + (c - 128)] = (bf16)f2bf(-x20); GNW[21 * 128 + (c - 128)] = (bf16)f2bf(-x21); GNW[22 * 128 + (c - 128)] = (bf16)f2bf(-x22); GNW[23 * 128 + (c - 128)] = (bf16)f2bf(-x23); GNW[24 * 128 + (c - 128)] = (bf16)f2bf(-x24); GNW[25 * 128 + (c - 128)] = (bf16)f2bf(-x25); GNW[26 * 128 + (c - 128)] = (bf16)f2bf(-x26); GNW[27 * 128 + (c - 128)] = (bf16)f2bf(-x27); GNW[28 * 128 + (c - 128)] = (bf16)f2bf(-x28); GNW[29 * 128 + (c - 128)] = (bf16)f2bf(-x29); GNW[30 * 128 + (c - 128)] = (bf16)f2bf(-x30); GNW[31 * 128 + (c - 128)] = (bf16)f2bf(-x31); GNW[32 * 128 + (c - 128)] = (bf16)f2bf(-x32); GNW[33 * 128 + (c - 128)] = (bf16)f2bf(-x33); GNW[34 * 128 + (c - 128)] = (bf16)f2bf(-x34); GNW[35 * 128 + (c - 128)] = (bf16)f2bf(-x35); GNW[36 * 128 + (c - 128)] = (bf16)f2bf(-x36); GNW[37 * 128 + (c - 128)] = (bf16)f2bf(-x37); GNW[38 * 128 + (c - 128)] = (bf16)f2bf(-x38); GNW[39 * 128 + (c - 128)] = (bf16)f2bf(-x39); GNW[40 * 128 + (c - 128)] = (bf16)f2bf(-x40); GNW[41 * 128 + (c - 128)] = (bf16)f2bf(-x41); GNW[42 * 128 + (c - 128)] = (bf16)f2bf(-x42); GNW[43 * 128 + (c - 128)] = (bf16)f2bf(-x43); GNW[44 * 128 + (c - 128)] = (bf16)f2bf(-x44); GNW[45 * 128 + (c - 128)] = (bf16)f2bf(-x45); GNW[46 * 128 + (c - 128)] = (bf16)f2bf(-x46); GNW[47 * 128 + (c - 128)] = (bf16)f2bf(-x47); GNW[48 * 128 + (c - 128)] = (bf16)f2bf(-x48); GNW[49 * 128 + (c - 128)] = (bf16)f2bf(-x49); GNW[50 * 128 + (c - 128)] = (bf16)f2bf(-x50); GNW[51 * 128 + (c - 128)] = (bf16)f2bf(-x51); GNW[52 * 128 + (c - 128)] = (bf16)f2bf(-x52); GNW[53 * 128 + (c - 128)] = (bf16)f2bf(-x53); GNW[54 * 128 + (c - 128)] = (bf16)f2bf(-x54); GNW[55 * 128 + (c - 128)] = (bf16)f2bf(-x55); GNW[56 * 128 + (c - 128)] = (bf16)f2bf(-x56); GNW[57 * 128 + (c - 128)] = (bf16)f2bf(-x57); GNW[58 * 128 + (c - 128)] = (bf16)f2bf(-x58); GNW[59 * 128 + (c - 128)] = (bf16)f2bf(-x59); GNW[60 * 128 + (c - 128)] = (bf16)f2bf(-x60); GNW[61 * 128 + (c - 128)] = (bf16)f2bf(-x61); GNW[62 * 128 + (c - 128)] = (bf16)f2bf(-x62); GNW[63 * 128 + (c - 128)] = (bf16)f2bf(-x63); }
#undef GDN_RHS
#undef GDN_L4
    } else {
        const int t2 = tid - 256; const float gl = gcs[63];
        { const int i = t2 >> 2, d0 = (t2 & 3) * 32; const float e = __expf(gcs[i]);
#pragma unroll
          for (int x8 = 0; x8 < 4; ++x8) { const v4f a = *(const LAS v4f*)(qs + i * QP + d0 + 8 * x8), b = *(const LAS v4f*)(qs + i * QP + d0 + 8 * x8 + 4);
              v4u w; w.x = pk2(a.x * e, a.y * e); w.y = pk2(a.z * e, a.w * e); w.z = pk2(b.x * e, b.y * e); w.w = pk2(b.z * e, b.w * e); *(v4u*)(GQG + i * 128 + d0 + 8 * x8) = w; } }
        { const int d = t2 >> 1, j0 = (t2 & 1) * 32;
#pragma unroll
          for (int x8 = 0; x8 < 4; ++x8) { float o[8];
#pragma unroll
              for (int x = 0; x < 8; ++x) { const int j = j0 + 8 * x8 + x; o[x] = ks[j * QP + d] * __expf(gl - gcs[j]); }
              v4u w; w.x = pk2(o[0], o[1]); w.y = pk2(o[2], o[3]); w.z = pk2(o[4], o[5]); w.w = pk2(o[6], o[7]); *(v4u*)(GKT + d * 64 + j0 + 8 * x8) = w; } }
        if (t2 == 0) GDL[item] = __expf(gl);
    }
    __syncthreads();
}
struct GdnFrags { bf16x8_t nw[4], qg[4], at[2], kt[2][2]; float u[4]; float dl; };
__device__ __forceinline__ void gdn_load(GdnFrags& F, const Params& p, int item, int off128, int off64, int offk, int offu) {
    const bf16* GNW = (const bf16*)(p.ws + WS_GNW) + (size_t)item * 8192; const bf16* GQG = (const bf16*)(p.ws + WS_GQG) + (size_t)item * 8192;
    const bf16* GAT = (const bf16*)(p.ws + WS_GAT) + (size_t)item * 4096; const bf16* GKT = (const bf16*)(p.ws + WS_GKT) + (size_t)item * 8192; const float* GU = (const float*)(p.ws + WS_GU) + (size_t)item * 8192;
#pragma unroll
    for (int ks = 0; ks < 4; ++ks) { F.nw[ks] = *(const bf16x8_t*)(GNW + off128 + 32 * ks); F.qg[ks] = *(const bf16x8_t*)(GQG + off128 + 32 * ks); }
#pragma unroll
    for (int ks = 0; ks < 2; ++ks) { F.at[ks] = *(const bf16x8_t*)(GAT + off64 + 32 * ks); F.kt[0][ks] = *(const bf16x8_t*)(GKT + offk + 32 * ks); F.kt[1][ks] = *(const bf16x8_t*)(GKT + offk + 1024 + 32 * ks); }
#pragma unroll
    for (int r = 0; r < 4; ++r) F.u[r] = GU[offu + r * 128];
    F.dl = ((const float*)(p.ws + WS_GDL))[item];
}
constexpr int STP = 136, VNP = 72;
__device__ __forceinline__ void gdn_seq(const Params& p, LAS unsigned char* lds, int wgi, int wave, int lane) {
    const int u = wgi * 2 + (wave >> 2), wi = wave & 3, h = u >> 3, sl = u & 7, g = lane >> 4, c = lane & 15;
    LAS unsigned short* ST = (LAS unsigned short*)(lds + (wave >> 2) * 12288);
    LAS unsigned short* VNT = ST + 2 * 16 * STP;
    float* GO = (float*)(p.ws + WS_GO);
    const int off128 = (16 * wi + c) * 128 + 8 * g, off64 = (16 * wi + c) * 64 + 8 * g, offk = (32 * wi + c) * 64 + 8 * g, offu = (16 * wi + 4 * g) * 128 + 16 * sl + c;
#pragma unroll
    for (int mt = 0; mt < 2; ++mt) *(LAS v2u*)(ST + c * STP + 16 * (2 * wi + mt) + 4 * g) = (v2u){0u, 0u};
    pg8::f32x4 Sacc[2] = {{0.f, 0.f, 0.f, 0.f}, {0.f, 0.f, 0.f, 0.f}};
    __syncthreads();
    GdnFrags F0, F1;
    gdn_load(F0, p, h, off128, off64, offk, offu);
#define GDN_STEP(F, n_) do { const int cur = (n_) & 1; bf16x8_t sf[4]; \
        _Pragma("unroll") for (int ks = 0; ks < 4; ++ks) sf[ks] = *(const LAS bf16x8_t*)(ST + cur * 16 * STP + c * STP + 32 * ks + 8 * g); \
        pg8::f32x4 vn = {F.u[0], F.u[1], F.u[2], F.u[3]}; \
        _Pragma("unroll") for (int ks = 0; ks < 4; ++ks) vn = __builtin_amdgcn_mfma_f32_16x16x32_bf16(F.nw[ks], sf[ks], vn, 0, 0, 0); \
        { v2u w; w.x = pk2(vn[0], vn[1]); w.y = pk2(vn[2], vn[3]); *(LAS v2u*)(VNT + c * VNP + 16 * wi + 4 * g) = w; } \
        LDS_BAR(); \
        const bf16x8_t v0 = *(const LAS bf16x8_t*)(VNT + c * VNP + 8 * g), v1 = *(const LAS bf16x8_t*)(VNT + c * VNP + 32 + 8 * g); \
        pg8::f32x4 o = {0.f, 0.f, 0.f, 0.f}; \
        _Pragma("unroll") for (int ks = 0; ks < 4; ++ks) o = __builtin_amdgcn_mfma_f32_16x16x32_bf16(F.qg[ks], sf[ks], o, 0, 0, 0); \
        o = __builtin_amdgcn_mfma_f32_16x16x32_bf16(F.at[0], v0, o, 0, 0, 0); o = __builtin_amdgcn_mfma_f32_16x16x32_bf16(F.at[1], v1, o, 0, 0, 0); \
        { const size_t tb = (size_t)(n_) * 64 + 16 * wi + 4 * g; _Pragma("unroll") for (int r = 0; r < 4; ++r) GO[(tb + r) * BW + h * 128 + 16 * sl + c] = o[r]; } \
        _Pragma("unroll") for (int mt = 0; mt < 2; ++mt) { Sacc[mt] = Sacc[mt] * F.dl; \
            Sacc[mt] = __builtin_amdgcn_mfma_f32_16x16x32_bf16(F.kt[mt][0], v0, Sacc[mt], 0, 0, 0); Sacc[mt] = __builtin_amdgcn_mfma_f32_16x16x32_bf16(F.kt[mt][1], v1, Sacc[mt], 0, 0, 0); \
            v2u w; w.x = pk2(Sacc[mt][0], Sacc[mt][1]); w.y = pk2(Sacc[mt][2], Sacc[mt][3]); *(LAS v2u*)(ST + (cur ^ 1) * 16 * STP + c * STP + 16 * (2 * wi + mt) + 4 * g) = w; } \
        LDS_BAR(); } while (0)
    for (int n = 0; n < T / 64; n += 2) {
        gdn_load(F1, p, (n + 1) * 4 + h, off128, off64, offk, offu);
        GDN_STEP(F0, n);
        gdn_load(F0, p, ((n + 2 < T / 64) ? n + 2 : n) * 4 + h, off128, off64, offk, offu);
        GDN_STEP(F1, n + 1);
    }
#undef GDN_STEP
}

constexpr int SEQ_UOFF = 132096;
constexpr int GI_NW = 0, GI_QG = 8704, GI_AT = 17408, GI_KT = 22016, GI_SZ = 31232;
struct GdnStage { v4u r[7]; float u[4]; float dl; };
__device__ __forceinline__ void gdn_stage_load(GdnStage& Sg, const Params& p, int item, int tid, int offu) {
    const bf16* GNW = (const bf16*)(p.ws + WS_GNW) + (size_t)item * 8192; const bf16* GQG = (const bf16*)(p.ws + WS_GQG) + (size_t)item * 8192;
    const bf16* GAT = (const bf16*)(p.ws + WS_GAT) + (size_t)item * 4096; const bf16* GKT = (const bf16*)(p.ws + WS_GKT) + (size_t)item * 8192; const float* GU = (const float*)(p.ws + WS_GU) + (size_t)item * 8192;
    Sg.r[0] = *(const v4u*)(GNW + 8 * tid); Sg.r[1] = *(const v4u*)(GNW + 8 * (tid + 512)); Sg.r[2] = *(const v4u*)(GQG + 8 * tid); Sg.r[3] = *(const v4u*)(GQG + 8 * (tid + 512));
    Sg.r[4] = *(const v4u*)(GAT + 8 * tid); Sg.r[5] = *(const v4u*)(GKT + 8 * tid); Sg.r[6] = *(const v4u*)(GKT + 8 * (tid + 512));
#pragma unroll
    for (int r = 0; r < 4; ++r) Sg.u[r] = GU[offu + r * 128];
    Sg.dl = ((const float*)(p.ws + WS_GDL))[item];
}
__device__ __forceinline__ void gdn_stage_write(const GdnStage& Sg, LAS unsigned short* img, int tid) {
    { const int p0 = tid, p1 = tid + 512;
      *(LAS v4u*)(img + GI_NW + (p0 >> 4) * 136 + 8 * (p0 & 15)) = Sg.r[0]; *(LAS v4u*)(img + GI_NW + (p1 >> 4) * 136 + 8 * (p1 & 15)) = Sg.r[1];
      *(LAS v4u*)(img + GI_QG + (p0 >> 4) * 136 + 8 * (p0 & 15)) = Sg.r[2]; *(LAS v4u*)(img + GI_QG + (p1 >> 4) * 136 + 8 * (p1 & 15)) = Sg.r[3];
      *(LAS v4u*)(img + GI_AT + (p0 >> 3) * 72 + 8 * (p0 & 7)) = Sg.r[4];
      *(LAS v4u*)(img + GI_KT + (p0 >> 3) * 72 + 8 * (p0 & 7)) = Sg.r[5]; *(LAS v4u*)(img + GI_KT + (p1 >> 3) * 72 + 8 * (p1 & 7)) = Sg.r[6]; }
}
__device__ __forceinline__ void gdn_seq2(const Params& p, LAS unsigned char* lds, int wgi, int tid, int wave, int lane) {
    const int h = wgi >> 2, sl = 2 * (wgi & 3) + (wave >> 2), wi = wave & 3, g = lane >> 4, c = lane & 15;
    LAS unsigned short* IMG = (LAS unsigned short*)lds;
    LAS unsigned short* ST = (LAS unsigned short*)(lds + SEQ_UOFF + (wave >> 2) * 12288);
    LAS unsigned short* VNT = ST + 2 * 16 * STP;
    float* GO = (float*)(p.ws + WS_GO);
    const int offu = (16 * wi + 4 * g) * 128 + 16 * sl + c;
#pragma unroll
    for (int mt = 0; mt < 2; ++mt) *(LAS v2u*)(ST + c * STP + 16 * (2 * wi + mt) + 4 * g) = (v2u){0u, 0u};
    pg8::f32x4 Sacc[2] = {{0.f, 0.f, 0.f, 0.f}, {0.f, 0.f, 0.f, 0.f}};
    GdnStage A, B;
    gdn_stage_load(A, p, h, tid, offu); gdn_stage_write(A, IMG, tid);
    gdn_stage_load(B, p, 4 + h, tid, offu);
    LDS_BAR();
    constexpr int NCH = T / 64;
#define GDN_STEP2(X, Y, n_) do { const int cur = (n_) & 1; const LAS unsigned short* im = IMG + cur * GI_SZ; bf16x8_t sf[4]; \
        _Pragma("unroll") for (int ks = 0; ks < 4; ++ks) sf[ks] = *(const LAS bf16x8_t*)(ST + cur * 16 * STP + c * STP + 32 * ks + 8 * g); \
        pg8::f32x4 vn = {X.u[0], X.u[1], X.u[2], X.u[3]}; const float dl = X.dl; \
        _Pragma("unroll") for (int ks = 0; ks < 4; ++ks) vn = __builtin_amdgcn_mfma_f32_16x16x32_bf16(*(const LAS bf16x8_t*)(im + GI_NW + (16 * wi + c) * 136 + 32 * ks + 8 * g), sf[ks], vn, 0, 0, 0); \
        { v2u w; w.x = pk2(vn[0], vn[1]); w.y = pk2(vn[2], vn[3]); *(LAS v2u*)(VNT + c * VNP + 16 * wi + 4 * g) = w; } \
        pg8::f32x4 o = {0.f, 0.f, 0.f, 0.f}; \
        _Pragma("unroll") for (int ks = 0; ks < 4; ++ks) o = __builtin_amdgcn_mfma_f32_16x16x32_bf16(*(const LAS bf16x8_t*)(im + GI_QG + (16 * wi + c) * 136 + 32 * ks + 8 * g), sf[ks], o, 0, 0, 0); \
        LDS_BAR(); \
        gdn_stage_load(X, p, (((n_) + 2 < NCH) ? (n_) + 2 : (n_)) * 4 + h, tid, offu); \
        const bf16x8_t v0 = *(const LAS bf16x8_t*)(VNT + c * VNP + 8 * g), v1 = *(const LAS bf16x8_t*)(VNT + c * VNP + 32 + 8 * g); \
        o = __builtin_amdgcn_mfma_f32_16x16x32_bf16(*(const LAS bf16x8_t*)(im + GI_AT + (16 * wi + c) * 72 + 8 * g), v0, o, 0, 0, 0); \
        o = __builtin_amdgcn_mfma_f32_16x16x32_bf16(*(const LAS bf16x8_t*)(im + GI_AT + (16 * wi + c) * 72 + 32 + 8 * g), v1, o, 0, 0, 0); \
        { const size_t tb = (size_t)(n_) * 64 + 16 * wi + 4 * g; _Pragma("unroll") for (int r = 0; r < 4; ++r) GO[(tb + r) * BW + h * 128 + 16 * sl + c] = o[r]; } \
        _Pragma("unroll") for (int mt = 0; mt < 2; ++mt) { Sacc[mt] = Sacc[mt] * dl; \
            Sacc[mt] = __builtin_amdgcn_mfma_f32_16x16x32_bf16(*(const LAS bf16x8_t*)(im + GI_KT + (16 * (2 * wi + mt) + c) * 72 + 8 * g), v0, Sacc[mt], 0, 0, 0); \
            Sacc[mt] = __builtin_amdgcn_mfma_f32_16x16x32_bf16(*(const LAS bf16x8_t*)(im + GI_KT + (16 * (2 * wi + mt) + c) * 72 + 32 + 8 * g), v1, Sacc[mt], 0, 0, 0); \
            v2u w; w.x = pk2(Sacc[mt][0], Sacc[mt][1]); w.y = pk2(Sacc[mt][2], Sacc[mt][3]); *(LAS v2u*)(ST + (cur ^ 1) * 16 * STP + c * STP + 16 * (2 * wi + mt) + 4 * g) = w; } \
        gdn_stage_write(Y, IMG + (cur ^ 1) * GI_SZ, tid); \
        LDS_BAR(); } while (0)
    for (int n = 0; n < NCH; n += 2) { GDN_STEP2(A, B, n); GDN_STEP2(B, A, n + 1); }
#undef GDN_STEP2
}
constexpr int MI_Q = 0, MI_S = 4608, MI_K = 9216, MI_SZ = 13824;
struct MlStage { v4u r[3]; bf16x8_t vt[2]; float fl; };
__device__ __forceinline__ void ml_stage_load(MlStage& Sg, const Params& p, int item, int tid, int offV) {
    const bf16* MQ = (const bf16*)(p.ws + WS_MQ) + (size_t)item * 4096; const bf16* MS = (const bf16*)(p.ws + WS_MS) + (size_t)item * 4096; const bf16* MK = (const bf16*)(p.ws + WS_MK) + (size_t)item * 4096;
    const bf16* MV = (const bf16*)(p.ws + WS_MV) + (size_t)item * 9216;
    Sg.r[0] = *(const v4u*)(MQ + 8 * tid); Sg.r[1] = *(const v4u*)(MS + 8 * tid); Sg.r[2] = *(const v4u*)(MK + 8 * tid);
    Sg.vt[0] = *(const bf16x8_t*)(MV + offV); Sg.vt[1] = *(const bf16x8_t*)(MV + offV + 32);
    Sg.fl = ((const float*)(p.ws + WS_MFL))[item];
}
__device__ __forceinline__ void ml_stage_write(const MlStage& Sg, LAS unsigned short* img, int tid) {
    const int o = (tid >> 3) * 72 + 8 * (tid & 7);
    *(LAS v4u*)(img + MI_Q + o) = Sg.r[0]; *(LAS v4u*)(img + MI_S + o) = Sg.r[1]; *(LAS v4u*)(img + MI_K + o) = Sg.r[2];
}
__device__ __forceinline__ void ml_seq2(const Params& p, LAS unsigned char* lds, int wgi, int tid, int wave, int lane) {
    const int h = wgi / 5, sl0 = 2 * (wgi % 5) + (wave >> 2), wi = wave & 3, g = lane >> 4, c = lane & 15;
    const bool real = sl0 < 9; const int sl = real ? sl0 : 8;
    LAS unsigned short* IMG = (LAS unsigned short*)lds;
    LAS unsigned short* CT = (LAS unsigned short*)(lds + SEQ_UOFF + (wave >> 2) * 8192);
    float* HO = (float*)(p.ws + WS_HO); float* HDEN = (float*)(p.ws + WS_HDEN);
    const int offV = (16 * sl + c) * 64 + 8 * g;
    *(LAS v2u*)(CT + c * 72 + 16 * wi + 4 * g) = (v2u){0u, 0u};
    pg8::f32x4 Cacc = {0.f, 0.f, 0.f, 0.f};
    MlStage A, B;
    ml_stage_load(A, p, h, tid, offV); ml_stage_write(A, IMG, tid);
    ml_stage_load(B, p, 4 + h, tid, offV);
    LDS_BAR();
    constexpr int NCH = T / 64;
#define ML_STEP2(X, Y, n_) do { const int cur = (n_) & 1; const LAS unsigned short* im = IMG + cur * MI_SZ; const int ro = (16 * wi + c) * 72 + 8 * g; \
        const bf16x8_t c0 = *(const LAS bf16x8_t*)(CT + cur * 16 * 72 + c * 72 + 8 * g), c1 = *(const LAS bf16x8_t*)(CT + cur * 16 * 72 + c * 72 + 32 + 8 * g); \
        const bf16x8_t vt0 = X.vt[0], vt1 = X.vt[1]; const float fl = X.fl; \
        pg8::f32x4 num = {0.f, 0.f, 0.f, 0.f}; \
        num = __builtin_amdgcn_mfma_f32_16x16x32_bf16(*(const LAS bf16x8_t*)(im + MI_Q + ro), c0, num, 0, 0, 0); num = __builtin_amdgcn_mfma_f32_16x16x32_bf16(*(const LAS bf16x8_t*)(im + MI_Q + ro + 32), c1, num, 0, 0, 0); \
        num = __builtin_amdgcn_mfma_f32_16x16x32_bf16(*(const LAS bf16x8_t*)(im + MI_S + ro), vt0, num, 0, 0, 0); num = __builtin_amdgcn_mfma_f32_16x16x32_bf16(*(const LAS bf16x8_t*)(im + MI_S + ro + 32), vt1, num, 0, 0, 0); \
        Cacc = Cacc * fl; \
        Cacc = __builtin_amdgcn_mfma_f32_16x16x32_bf16(*(const LAS bf16x8_t*)(im + MI_K + ro), vt0, Cacc, 0, 0, 0); Cacc = __builtin_amdgcn_mfma_f32_16x16x32_bf16(*(const LAS bf16x8_t*)(im + MI_K + ro + 32), vt1, Cacc, 0, 0, 0); \
        ml_stage_load(X, p, (((n_) + 2 < NCH) ? (n_) + 2 : (n_)) * 4 + h, tid, offV); \
        { v2u w; w.x = pk2(Cacc[0], Cacc[1]); w.y = pk2(Cacc[2], Cacc[3]); *(LAS v2u*)(CT + (cur ^ 1) * 16 * 72 + c * 72 + 16 * wi + 4 * g) = w; } \
        { const size_t tb = (size_t)(n_) * 64 + 16 * wi + 4 * g; \
          if (sl < 8) { _Pragma("unroll") for (int r = 0; r < 4; ++r) HO[(tb + r) * BW + h * 128 + 16 * sl + c] = num[r]; } \
          else if (c == 0 && real) { _Pragma("unroll") for (int r = 0; r < 4; ++r) HDEN[(tb + r) * 4 + h] = num[r]; } } \
        ml_stage_write(Y, IMG + (cur ^ 1) * MI_SZ, tid); \
        LDS_BAR(); } while (0)
    for (int n = 0; n < NCH; n += 2) { ML_STEP2(A, B, n); ML_STEP2(B, A, n + 1); }
#undef ML_STEP2
}

__device__ __forceinline__ void mixer_gmlp_item(const Params& p, int l, LAS unsigned char* lds, int item, int tid, int wave, int lane) {
    const int chunk = item >> 1, hf = item & 1; const size_t tok0 = (size_t)chunk * 128;
    const bf16* Z = (const bf16*)(p.ws + WS_Z);
    const float* ng = p.in[I_GMNG] + l * BW; const float* nb = p.in[I_GMNB] + l * BW;
    LAS unsigned short* vT = (LAS unsigned short*)lds;
    {   v4u raw[16];
#pragma unroll
        for (int r = 0; r < 16; ++r) raw[r] = *(const v4u*)(Z + (tok0 + wave * 16 + r) * ZC + ZC_GMV + 8 * lane);
        float gn[8], gb[8];
#pragma unroll
        for (int i = 0; i < 8; ++i) { gn[i] = ng[8 * lane + i]; gb[i] = nb[8 * lane + i]; }
#pragma unroll
        for (int r = 0; r < 16; ++r) { const int tk = wave * 16 + r; float x[8]; unpack8(raw[r], x); float s = 0.f;
#pragma unroll
            for (int i = 0; i < 8; ++i) { x[i] = gelu_tanh(x[i]); s += x[i]; }
            const float mean = wave_sum(s) * (1.f / 512.f); float ss = 0.f;
#pragma unroll
            for (int i = 0; i < 8; ++i) { x[i] -= mean; ss += x[i] * x[i]; }
            const float rstd = rsqrtf(wave_sum(ss) * (1.f / 512.f) + LN_EPS);
            if ((lane >> 5) == hf) { const int cl = ((lane >> 4) & 1) * 128 * 136 + 8 * (lane & 15) * 136;
#pragma unroll
                for (int i = 0; i < 8; ++i) vT[cl + i * 136 + tk] = (unsigned short)f2bf(x[i] * rstd * gn[i] + gb[i]); } } }
    __syncthreads();
#pragma unroll 1
    for (int gl = 0; gl < 2; ++gl) { const int g = 2 * hf + gl; const LAS unsigned short* vg = vT + gl * 128 * 136;
        const float* wsp = p.in[I_GMWS] + ((size_t)(l * 4 + g) * 128) * 128; const float* bsp = p.in[I_GMBS] + (l * 4 + g) * 128;
        const int c16 = lane & 15, g4 = lane >> 4, t = 16 * wave + c16, nks = ((16 * wave + 15) >> 5) + 1;
        bf16x8_t wf[4];
#pragma unroll
        for (int ks = 0; ks < 4; ++ks) { wf[ks] = (bf16x8_t){0, 0, 0, 0, 0, 0, 0, 0};
            if (ks < nks) { const float* wp = wsp + (size_t)t * 128 + 32 * ks + 8 * g4; const v4f a = *(const v4f*)wp, b = *(const v4f*)(wp + 4); const int s0 = 32 * ks + 8 * g4;
                const v4u w = (v4u){pk2(s0 <= t ? a.x : 0.f, s0 + 1 <= t ? a.y : 0.f), pk2(s0 + 2 <= t ? a.z : 0.f, s0 + 3 <= t ? a.w : 0.f), pk2(s0 + 4 <= t ? b.x : 0.f, s0 + 5 <= t ? b.y : 0.f), pk2(s0 + 6 <= t ? b.z : 0.f, s0 + 7 <= t ? b.w : 0.f)};
                wf[ks] = __builtin_bit_cast(bf16x8_t, w); } }
        pg8::f32x4 acc[8];
#pragma unroll
        for (int ct = 0; ct < 8; ++ct) acc[ct] = (pg8::f32x4){0.f, 0.f, 0.f, 0.f};
#pragma unroll
        for (int ks = 0; ks < 4; ++ks) { if (ks < nks) {
#pragma unroll
            for (int ct = 0; ct < 8; ++ct) acc[ct] = __builtin_amdgcn_mfma_f32_16x16x32_bf16(*(const LAS bf16x8_t*)(vg + (16 * ct + c16) * 136 + 32 * ks + 8 * g4), wf[ks], acc[ct], 0, 0, 0); } }
        const float bias = bsp[t]; v2u ur[8];
#pragma unroll
        for (int ct = 0; ct < 8; ++ct) ur[ct] = *(const v2u*)(Z + (tok0 + t) * ZC + ZC_GMU + g * 128 + 16 * ct + 4 * g4);
#pragma unroll
        for (int ct = 0; ct < 8; ++ct) { const float u0 = bflo(ur[ct].x), u1 = bfhi(ur[ct].x), u2 = bflo(ur[ct].y), u3 = bfhi(ur[ct].y);
            const float o0 = gelu_tanh(u0) * (acc[ct][0] + bias), o1 = gelu_tanh(u1) * (acc[ct][1] + bias), o2 = gelu_tanh(u2) * (acc[ct][2] + bias), o3 = gelu_tanh(u3) * (acc[ct][3] + bias);
#if MERGE_FP8
            *(unsigned*)((unsigned char*)(p.ws + WS_BR) + (tok0 + t) * BRW + 1 * BW + g * 128 + 16 * ct + 4 * g4) = pk4_f8(o0, o1, o2, o3, BRSC); }
#else
            *(v2u*)((bf16*)(p.ws + WS_BR) + (tok0 + t) * BRW + 1 * BW + g * 128 + 16 * ct + 4 * g4) = (v2u){pk2(o0, o1), pk2(o2, o3)}; }
#endif
    }
    __syncthreads();
}

__device__ __forceinline__ void vt_item(const Params& p, LAS unsigned char* lds, int item, int tid) {
    const int h = item & 3, n = item >> 2; const size_t t0 = (size_t)n * 64;
    const bf16* Z = (const bf16*)(p.ws + WS_Z); bf16* VT = (bf16*)(p.ws + WS_VT);
    LAS unsigned short* vs = (LAS unsigned short*)lds;
#pragma unroll
    for (int r = 0; r < 2; ++r) { const int idx = tid + 512 * r, tk = idx >> 4, c8 = idx & 15;
        *(LAS v4u*)(vs + tk * 136 + 8 * c8) = *(const v4u*)(Z + (t0 + tk) * ZC + ZC_SBV + h * 128 + 8 * c8); }
    __syncthreads();
    { const int d = tid >> 2, jq = tid & 3; unsigned w[8];
#pragma unroll
      for (int x = 0; x < 8; ++x) w[x] = (unsigned)vs[(16 * jq + 2 * x) * 136 + d] | ((unsigned)vs[(16 * jq + 2 * x + 1) * 136 + d] << 16);
      bf16* dst = VT + ((size_t)h * 128 + d) * T + t0 + 16 * jq;
      *(v4u*)dst = (v4u){w[0], w[1], w[2], w[3]}; *(v4u*)(dst + 8) = (v4u){w[4], w[5], w[6], w[7]}; }
    __syncthreads();
}
constexpr int KTP = 136, VTP = 72;
__device__ __forceinline__ void sb_unit(const Params& p, LAS unsigned char* lds, int unit, int tid, int wave, int lane) {
    const int h = unit >> 6, q0 = (unit & 63) * 128, g = lane >> 4, c = lane & 15; const int qrow = q0 + 16 * wave + c;
    const bf16* Z = (const bf16*)(p.ws + WS_Z); const bf16* VT = (const bf16*)(p.ws + WS_VT) + (size_t)h * 128 * T; bf16* BR0 = (bf16*)(p.ws + WS_BR);
    LAS unsigned short* Kt = (LAS unsigned short*)lds;
    LAS unsigned short* Vt = Kt + 2 * 64 * KTP;
    LAS int* flags = (LAS int*)(Vt + 2 * 128 * VTP);
    bf16x8_t qf[4];
#pragma unroll
    for (int ks = 0; ks < 4; ++ks) qf[ks] = *(const bf16x8_t*)(Z + (size_t)qrow * ZC + ZC_SBQ + h * 128 + 32 * ks + 8 * g);
    pg8::f32x4 acc[8];
#pragma unroll
    for (int dt = 0; dt < 8; ++dt) acc[dt] = (pg8::f32x4){0.f, 0.f, 0.f, 0.f};
    float racc = 0.f;
    v4u kr[2], vr[2];
    const int jt = (q0 >> 6) + 1;
#define SB_GLOAD(j_) do { _Pragma("unroll") for (int r = 0; r < 2; ++r) { const int idx = tid + 512 * r; \
        kr[r] = *(const v4u*)(Z + (size_t)(64 * (j_) + (idx >> 4)) * ZC + ZC_SBK + h * 128 + 8 * (idx & 15)); \
        vr[r] = *(const v4u*)(VT + (size_t)(idx >> 3) * T + 64 * (j_) + 8 * (idx & 7)); } } while (0)
#define SB_LWRITE(b_) do { _Pragma("unroll") for (int r = 0; r < 2; ++r) { const int idx = tid + 512 * r; \
        *(LAS v4u*)(Kt + (b_) * 64 * KTP + (idx >> 4) * KTP + 8 * (idx & 15)) = kr[r]; *(LAS v4u*)(Vt + (b_) * 128 * VTP + (idx >> 3) * VTP + 8 * (idx & 7)) = vr[r]; } } while (0)
    LDS_BAR();
    SB_GLOAD(jt); SB_LWRITE(0);
    LDS_BAR();
    for (int j = jt, it = 0; j >= 0; --j, ++it) {
        const int cur = it & 1;
        SB_GLOAD(j > 0 ? j - 1 : 0);
        const bool wdone = __all(racc > 104.f);
        if (64 * j < q0 + 16 * wave + 15 && !wdone) {
            const LAS unsigned short* Kc = Kt + cur * 64 * KTP; const LAS unsigned short* Vc = Vt + cur * 128 * VTP;
            pg8::f32x4 z[4];
#pragma unroll
            for (int s = 0; s < 4; ++s) { z[s] = (pg8::f32x4){0.f, 0.f, 0.f, 0.f};
#pragma unroll
                for (int ks = 0; ks < 4; ++ks) z[s] = __builtin_amdgcn_mfma_f32_16x16x32_bf16(*(const LAS bf16x8_t*)(Kc + (16 * s + c) * KTP + 32 * ks + 8 * g), qf[ks], z[s], 0, 0, 0); }
            float sp[4][4], t[4], xs[4]; bool mk[4][4];
#pragma unroll
            for (int s = 0; s < 4; ++s) { t[s] = 0.f;
#pragma unroll
                for (int r = 0; r < 4; ++r) { const int key = 64 * j + 16 * s + 4 * g + r; mk[s][r] = key < qrow; const float zz = z[s][r] * 0.08838834764831845f; z[s][r] = zz;
                    sp[s][r] = mk[s][r] ? softplusf_(zz) : 0.f; t[s] += sp[s][r]; } }
            float grand = 0.f, higher[4];
#pragma unroll
            for (int s = 3; s >= 0; --s) { float x = t[s]; float y = __shfl(x, lane + 16); x += (g < 3) ? y : 0.f; y = __shfl(x, lane + 32); x += (g < 2) ? y : 0.f;
                xs[s] = x - t[s];
                const float tot = __shfl(x, c); higher[s] = grand; grand += tot; }
            bf16x8_t pf[2];
#pragma unroll
            for (int s = 0; s < 4; ++s) { float a[4]; float e = 0.f;
#pragma unroll
                for (int r = 3; r >= 0; --r) { const float la = z[s][r] - sp[s][r] - (racc + higher[s] + xs[s] + e); a[r] = mk[s][r] ? __expf(la) : 0.f; e += sp[s][r]; }
                const unsigned w0 = pk2(a[0], a[1]), w1 = pk2(a[2], a[3]);
                if ((s & 1) == 0) { pf[s >> 1][0] = (short)(w0 & 0xffff); pf[s >> 1][1] = (short)(w0 >> 16); pf[s >> 1][2] = (short)(w1 & 0xffff); pf[s >> 1][3] = (short)(w1 >> 16); }
                else              { pf[s >> 1][4] = (short)(w0 & 0xffff); pf[s >> 1][5] = (short)(w0 >> 16); pf[s >> 1][6] = (short)(w1 & 0xffff); pf[s >> 1][7] = (short)(w1 >> 16); } }
            racc += grand;
#pragma unroll
            for (int dt = 0; dt < 8; ++dt)
#pragma unroll
                for (int k2 = 0; k2 < 2; ++k2) { const v2u lo = *(const LAS v2u*)(Vc + (16 * dt + c) * VTP + 32 * k2 + 4 * g), hi = *(const LAS v2u*)(Vc + (16 * dt + c) * VTP + 32 * k2 + 16 + 4 * g);
                    const v4u vv = (v4u){lo.x, lo.y, hi.x, hi.y};
                    acc[dt] = __builtin_amdgcn_mfma_f32_16x16x32_bf16(__builtin_bit_cast(bf16x8_t, vv), pf[k2], acc[dt], 0, 0, 0); }
        }
        const bool wd2 = __all(racc > 104.f);
        if (lane == 0) flags[cur * 8 + wave] = wd2 ? 1 : 0;
        SB_LWRITE(cur ^ 1);
        LDS_BAR();
        int alld = 1;
#pragma unroll
        for (int w = 0; w < 8; ++w) alld &= flags[cur * 8 + w];
        if (alld) break;
    }
#undef SB_GLOAD
#undef SB_LWRITE
#pragma unroll
#if MERGE_FP8
    for (int dt = 0; dt < 8; ++dt) *(unsigned*)((unsigned char*)BR0 + (size_t)qrow * BRW + h * 128 + 16 * dt + 4 * g) = pk4_f8(acc[dt][0], acc[dt][1], acc[dt][2], acc[dt][3], BRSC);
#else
    for (int dt = 0; dt < 8; ++dt) { v2u w; w.x = pk2(acc[dt][0], acc[dt][1]); w.y = pk2(acc[dt][2], acc[dt][3]); *(v2u*)(BR0 + (size_t)qrow * BRW + h * 128 + 16 * dt + 4 * g) = w; }
#endif
}

struct GateOrder {
    pg8::StaticOrder s; int pn0;
    __device__ __forceinline__ bool next(int i, pg8::Unit& u) const { if (!s.next(i, u)) return false; u.pn += pn0; return true; }
    __device__ __forceinline__ void a_ready(const pg8::Unit&) const {}
    __device__ __forceinline__ void done(const pg8::Unit&) const {}
};
constexpr int GATE_PN0 = ZC_GATE / 256, GATE_WGS = 128;
__device__ __forceinline__ void phase_mixers(const Params& p, int l, LAS unsigned char* lds, int wg, int G, int tid, int wave, int lane, const XcdBarrier& bar) {
#if defined(PROBE_SPLIT)
    if (wg < 16) gdn_seq2(p, lds, wg, tid, wave, lane); else if (wg < 36) ml_seq2(p, lds, wg - 16, tid, wave, lane);
    xcd_barrier(bar);
    const int w2 = wg, G2 = G;
#else
    if (wg < 16) { gdn_seq2(p, lds, wg, tid, wave, lane); return; }
    if (wg < 36) { ml_seq2(p, lds, wg - 16, tid, wave, lane); return; }
    const int w2 = wg - 36, G2 = G - 36;
#endif
    if (GATE_SPLIT && G == 256) {
        if (w2 < GATE_WGS) {
            for (int it = w2; it < 128; it += GATE_WGS) mixer_gmlp_item(p, l, lds, it, tid, wave, lane);
            for (int it = w2; it < 256; it += GATE_WGS) sb_unit(p, lds, it, tid, wave, lane);
            __syncthreads();
            pg8::Gemm g{(const bf16*)(p.ws + WS_XB), (const bf16*)(p.ws + WS_WIN), T, ZC, D / 2, D / 2, D / 2}; GateOrder S; S.s.init(T, ZC - ZC_GATE, GATE_WGS, w2); S.pn0 = GATE_PN0;
#if GATE_FP8
            EpiGate8 E{p.ws + WS_MTMP, 1.f / 64.f};
            pg8::gemm_phase<EpiGate8, GateOrder, true, true, true>(lds, g, S, E);
#else
            pg8::EpiBf16<0> E{(bf16*)(p.ws + WS_Z), ZC, nullptr, 0, 0, 1.f / 64.f};
            pg8::gemm_phase<pg8::EpiBf16<0>, GateOrder, true, true, true>(lds, g, S, E);
#endif
        } else { const int w3 = w2 - GATE_WGS, G3 = G2 - GATE_WGS; __syncthreads();
            phase_convert<1>(p, l, lds, w3 * 8 + wave, G3 * 8, wave, lane); }
        return; }
    for (int it = w2; it < 128; it += G2) mixer_gmlp_item(p, l, lds, it, tid, wave, lane);
    for (int it = w2; it < 256; it += G2) sb_unit(p, lds, it, tid, wave, lane);
#if !defined(PROBE_CONV0)
    __syncthreads();
    {
        constexpr int NIT1 = (NEX * 2 * (D / 64) * (ED / 32)) + (NEX * (ED / 64) * (D / 32));
        const int nheavy = (G2 < 256 && 2 * G2 >= 256) ? 256 - G2 : 0, per_wave = NIT1 / (G2 * 8);
        const int NA = (nheavy > 0 && per_wave > 2 * CONV_SKIP) ? (per_wave - CONV_SKIP) * (G2 * 8) : NIT1;
        phase_convert<1>(p, l, lds, w2 * 8 + wave, G2 * 8, wave, lane, false, 0, NA);
        if (NA < NIT1 && w2 >= nheavy) phase_convert<1>(p, l, lds, (w2 - nheavy) * 8 + wave, (G2 - nheavy) * 8, wave, lane, false, NA, NIT1); }
#endif
}

__device__ __forceinline__ void phase_post(const Params& p, int l, int gw, int NGW, int lane) {
    const bf16* Z = (const bf16*)(p.ws + WS_Z); const float* GO = (const float*)(p.ws + WS_GO); const float* HO = (const float*)(p.ws + WS_HO); const float* HDEN = (const float*)(p.ws + WS_HDEN);
    bf16* BR2 = (bf16*)(p.ws + WS_BR) + 2 * BW; bf16* BR3 = (bf16*)(p.ws + WS_BR) + 3 * BW;
    const float* gng = p.in[I_GDNNG] + l * 128; const float* mng = p.in[I_MLNG] + l * BW;
    for (int t = gw; t < T; t += NGW) {
        {   const v4f a0 = *(const v4f*)(GO + (size_t)t * BW + 8 * lane), a1 = *(const v4f*)(GO + (size_t)t * BW + 8 * lane + 4); float o[8] = {a0.x, a0.y, a0.z, a0.w, a1.x, a1.y, a1.z, a1.w}; float ss = 0.f;
#pragma unroll
            for (int i = 0; i < 8; ++i) ss += o[i] * o[i];
            const float r = rsqrtf(sum16(ss) * (1.f / 128.f) + LN_EPS);
            const v4u graw = *(const v4u*)(Z + (size_t)t * ZC + ZC_GDNG + 8 * lane); float gt[8]; unpack8(graw, gt);
#pragma unroll
            for (int i = 0; i < 8; ++i) o[i] = o[i] * r * gng[(8 * lane + i) & 127] * siluf_(gt[i]);
#if MERGE_FP8
            *(v2u*)((unsigned char*)(p.ws + WS_BR) + (size_t)t * BRW + 2 * BW + 8 * lane) = (v2u){pk4_f8(o[0], o[1], o[2], o[3], BRSC), pk4_f8(o[4], o[5], o[6], o[7], BRSC)}; }
#else
            v4u w; w.x = pk2(o[0], o[1]); w.y = pk2(o[2], o[3]); w.z = pk2(o[4], o[5]); w.w = pk2(o[6], o[7]); *(v4u*)(BR2 + (size_t)t * BRW + 8 * lane) = w; }
#endif
        {   const v4f a0 = *(const v4f*)(HO + (size_t)t * BW + 8 * lane), a1 = *(const v4f*)(HO + (size_t)t * BW + 8 * lane + 4); float o[8] = {a0.x, a0.y, a0.z, a0.w, a1.x, a1.y, a1.z, a1.w}; float ss = 0.f;
            const float dn = __builtin_amdgcn_rcpf(fmaxf(fabsf(HDEN[(size_t)t * 4 + (lane >> 4)]), 1.f));
#pragma unroll
            for (int i = 0; i < 8; ++i) { o[i] *= dn; ss += o[i] * o[i]; }
            const float r = rsqrtf(sum16(ss) * (1.f / 128.f) + LN_EPS);
            const v4u graw = *(const v4u*)(Z + (size_t)t * ZC + ZC_MLO + 8 * lane); float gt[8]; unpack8(graw, gt);
#pragma unroll
            for (int i = 0; i < 8; ++i) o[i] = o[i] * r * mng[8 * lane + i] * sigmoidf_(gt[i]);
#if MERGE_FP8
            *(v2u*)((unsigned char*)(p.ws + WS_BR) + (size_t)t * BRW + 3 * BW + 8 * lane) = (v2u){pk4_f8(o[0], o[1], o[2], o[3], BRSC), pk4_f8(o[4], o[5], o[6], o[7], BRSC)}; }
#else
            v4u w; w.x = pk2(o[0], o[1]); w.y = pk2(o[2], o[3]); w.z = pk2(o[4], o[5]); w.w = pk2(o[6], o[7]); *(v4u*)(BR3 + (size_t)t * BRW + 8 * lane) = w; }
#endif
    }
}

__device__ __forceinline__ void ln_row(const float* yrow, const float* g, const float* b, int lane, v4f (&v)[8]) {
    const v4f* yr = (const v4f*)yrow + lane; float s = 0.f;
#pragma unroll
    for (int j = 0; j < 8; ++j) { v[j] = yr[64 * j]; s += (v[j].x + v[j].y) + (v[j].z + v[j].w); }
    const float mean = wave_sum(s) * (1.f / D); float s2 = 0.f;
#pragma unroll
    for (int j = 0; j < 8; ++j) { v[j] = v[j] - mean; s2 += (v[j].x * v[j].x + v[j].y * v[j].y) + (v[j].z * v[j].z + v[j].w * v[j].w); }
    const float rstd = rsqrtf(wave_sum(s2) * (1.f / D) + LN_EPS);
#pragma unroll
    for (int j = 0; j < 8; ++j) { const v4f gg = ((const v4f*)g)[lane + 64 * j], bb = ((const v4f*)b)[lane + 64 * j]; v[j] = v[j] * rstd * gg + bb; }
}
constexpr int RT_XP = 2052;
constexpr int RT_TAB = 131072 + 1024;
__device__ __forceinline__ void phase_ln1_router(const Params& p, int l, LAS unsigned char* lds, int wg, int G, int wave, int lane, int cnt_shift = 0) {
    const bf16* Y = (const bf16*)(p.ws + WS_Y); bf16* X1 = (bf16*)(p.ws + WS_X1); bf16* X1B = (bf16*)(p.ws + WS_X1B); int* LIST = (int*)(p.ws + WS_LIST); float* WL = (float*)(p.ws + WS_WL); unsigned* SLOT = (unsigned*)(p.ws + WS_SLOT);
    unsigned* cnt = (unsigned*)(p.ws + WS_CTL) + CW_CNT + l * 4096 + cnt_shift;
    const float* g1 = p.in[I_LN1G] + (size_t)l * D; const float* b1 = p.in[I_LN1B] + (size_t)l * D;
    const float* wr = p.in[I_WR] + (size_t)l * D * NE; const float rbias = p.in[I_RB][l * NE + lane];
    LAS float* xt = (LAS float*)lds;
    LAS float* part = (LAS float*)lds;
    LAS unsigned char* selm = lds + RT_TAB; LAS unsigned char* rkm = selm + 4096; LAS float* wtm = (LAS float*)(rkm + 4096); LAS unsigned* basem = (LAS unsigned*)(wtm + 4096);
    const int n_l = lane & 15, kq = lane >> 4;
    int gi = 0;
    for (int tg = wg; tg < T / 16; tg += G, ++gi) {
        {   v4f va[8], vb[8]; const size_t m0 = (size_t)tg * 16 + 2 * wave;
#pragma unroll
            for (int j = 0; j < 8; ++j) { va[j] = ld4(Y, m0 * D + 4 * lane + 256 * j, true); vb[j] = ld4(Y, (m0 + 1) * D + 4 * lane + 256 * j, true); }
            float sa = 0.f, sb = 0.f;
#pragma unroll
            for (int j = 0; j < 8; ++j) { sa += (va[j].x + va[j].y) + (va[j].z + va[j].w); sb += (vb[j].x + vb[j].y) + (vb[j].z + vb[j].w); }
            const float ma = wave_sum(sa) * (1.f / D), mb = wave_sum(sb) * (1.f / D); float qa = 0.f, qb = 0.f;
#pragma unroll
            for (int j = 0; j < 8; ++j) { va[j] = va[j] - ma; vb[j] = vb[j] - mb; qa += (va[j].x * va[j].x + va[j].y * va[j].y) + (va[j].z * va[j].z + va[j].w * va[j].w); qb += (vb[j].x * vb[j].x + vb[j].y * vb[j].y) + (vb[j].z * vb[j].z + vb[j].w * vb[j].w); }
            const float ra = rsqrtf(wave_sum(qa) * (1.f / D) + LN_EPS), rb = rsqrtf(wave_sum(qb) * (1.f / D) + LN_EPS);
#pragma unroll
            for (int j = 0; j < 8; ++j) { const v4f gg = ((const v4f*)g1)[lane + 64 * j], bb = ((const v4f*)b1)[lane + 64 * j]; va[j] = va[j] * ra * gg + bb; vb[j] = vb[j] * rb * gg + bb; }
#pragma unroll
            for (int rr = 0; rr < 2; ++rr) { const size_t m = m0 + rr; v2u* xo = (v2u*)(X1 + m * D) + lane;
#pragma unroll
                for (int j = 0; j < 8; ++j) { const v4f v = rr ? vb[j] : va[j]; xo[64 * j] = (v2u){pk2(v.x, v.y), pk2(v.z, v.w)};
#if MOE_UP_FP8
                    { unsigned w = 0; w = __builtin_amdgcn_cvt_pk_fp8_f32(v.x, v.y, w, false); w = __builtin_amdgcn_cvt_pk_fp8_f32(v.z, v.w, w, true); ((unsigned*)((unsigned char*)X1B + m * D))[lane + 64 * j] = w; }
#else
                    { v2u o; o.x = pk2(v.x, v.y); o.y = pk2(v.z, v.w); ((v2u*)(X1B + m * D))[lane + 64 * j] = o; }
#endif
                    *(LAS v4f*)(xt + (2 * wave + rr) * RT_XP + 4 * lane + 256 * j) = v; } } }
        __syncthreads();
        {   pg8::f32x4 acc[4];
#pragma unroll
            for (int i = 0; i < 4; ++i) acc[i] = (pg8::f32x4){0.f, 0.f, 0.f, 0.f};
            const float* wb = wr + (size_t)(256 * wave + 4 * kq) * NE + 4 * n_l;
            const LAS float* xa = xt + n_l * RT_XP + 256 * wave + 4 * kq;
            v4f bwa[16], bwb[16];
#define RT_LOADW(dst, sb_) do { _Pragma("unroll") for (int q = 0; q < 16; ++q) dst[q] = *(const v4f*)(wb + (size_t)(16 * (4 * (sb_) + (q >> 2)) + (q & 3)) * NE); } while (0)
#define RT_MMA(src, sb_) do { _Pragma("unroll") for (int sg = 0; sg < 4; ++sg) { const v4f a4 = *(const LAS v4f*)(xa + 16 * (4 * (sb_) + sg)); \
                _Pragma("unroll") for (int c = 0; c < 4; ++c) { const v4f b4 = src[sg * 4 + c]; const float a = c == 0 ? a4.x : c == 1 ? a4.y : c == 2 ? a4.z : a4.w; \
                    acc[0] = __builtin_amdgcn_mfma_f32_16x16x4f32(a, b4.x, acc[0], 0, 0, 0); acc[1] = __builtin_amdgcn_mfma_f32_16x16x4f32(a, b4.y, acc[1], 0, 0, 0); \
                    acc[2] = __builtin_amdgcn_mfma_f32_16x16x4f32(a, b4.z, acc[2], 0, 0, 0); acc[3] = __builtin_amdgcn_mfma_f32_16x16x4f32(a, b4.w, acc[3], 0, 0, 0); } } } while (0)
            RT_LOADW(bwa, 0);
#pragma unroll 1
            for (int h = 0; h < 2; ++h) {
                RT_LOADW(bwb, 1); RT_MMA(bwa, 0);
                if (h == 0) RT_LOADW(bwa, 2);
                RT_MMA(bwb, 1);
                wb += (size_t)128 * NE; xa += 128; asm volatile("" : "+v"(wb));
            }
#undef RT_LOADW
#undef RT_MMA
            __syncthreads();
#pragma unroll
            for (int j = 0; j < 4; ++j) *(LAS v4f*)(part + (wave * 16 + 4 * kq + j) * 64 + 4 * n_l) = (v4f){acc[0][j], acc[1][j], acc[2][j], acc[3][j]}; }
        __syncthreads();
#pragma unroll 1
        for (int rr = 0; rr < 2; ++rr) { const int lr = wave + 8 * rr; float logit = 0.f;
#pragma unroll
            for (int w = 0; w < 8; ++w) logit += part[(w * 16 + lr) * 64 + lane];
            const float s = sigmoid_div(logit), biased = s + rbias;
            const float m1 = max8(biased); const float li = (float)(lane & 7);
            const float first = min8(biased == m1 ? li : 8.f);
            const float m2 = max8(li == first ? -INFINITY : biased);
            const float gs = m1 + m2; const int myg = lane >> 3; int grank = 0;
#pragma unroll
            for (int g2 = 0; g2 < 8; ++g2) { const float o = __builtin_bit_cast(float, __builtin_amdgcn_readlane(__builtin_bit_cast(int, gs), g2 * 8)); grank += (o > gs || (o == gs && g2 < myg)) ? 1 : 0; }
            const float masked = grank < 4 ? biased : -INFINITY; int rank = 0;
#pragma unroll 8
            for (int e2 = 0; e2 < 64; ++e2) { const float o = __builtin_bit_cast(float, __builtin_amdgcn_readlane(__builtin_bit_cast(int, masked), e2)); rank += (o > masked || (o == masked && e2 < lane)) ? 1 : 0; }
            const float wsel = rank < 6 ? s : 0.f; const float tot = wave_sum(wsel);
            const int ri = gi * 16 + lr;
            selm[ri * 64 + lane] = (rank < 6) ? 1 : 0; rkm[ri * 64 + lane] = (unsigned char)rank; wtm[ri * 64 + lane] = wsel / tot * 2.5f; }
        __syncthreads();
    }
    const int nrows = gi * 16;
    if (wave == 0) { unsigned n = 0;
        for (int r = 0; r < nrows; ++r) n += selm[r * 64 + lane];
        unsigned base = 0; if (n && !(PROBE_NOATOM && cnt_shift)) base = __hip_atomic_fetch_add(cnt + 64 * lane, n, __ATOMIC_RELAXED, __HIP_MEMORY_SCOPE_AGENT);
        basem[lane] = base; }
    __syncthreads();
    for (int ri = wave; ri < nrows; ri += 8) { unsigned pos = basem[lane];
        for (int r = 0; r < ri; ++r) pos += selm[r * 64 + lane];
        if (selm[ri * 64 + lane]) { const size_t m = (size_t)(wg + (ri >> 4) * G) * 16 + (ri & 15); const int rk = rkm[ri * 64 + lane];
            LIST[lane * T + pos] = (int)m; WL[lane * T + pos] = wtm[ri * 64 + lane]; SLOT[m * 8 + rk] = ((unsigned)lane << 16) | pos; } }
    __syncthreads();
}
__device__ __forceinline__ void phase_combine_ln2(const Params& p, int l, void* dst, bool dbf, int gw, int NGW, int lane) {
    const bf16* X1 = (const bf16*)(p.ws + WS_X1); const bf16* YE = (const bf16*)(p.ws + WS_YEXP); const unsigned* SLOT = (const unsigned*)(p.ws + WS_SLOT);
    const unsigned* cnt = (const unsigned*)(p.ws + WS_CTL) + CW_CNT + l * 4096;
    const float* g2 = p.in[I_LN2G] + (size_t)l * D; const float* b2 = p.in[I_LN2B] + (size_t)l * D;
    const int tiles = ((int)cnt[64 * lane] + 255) >> 8; const float incl = wave_scan_incl((float)tiles);
    const int toff = (int)incl - tiles;
    const int tsh = __builtin_amdgcn_readlane((int)incl, 63);
    for (int m = gw; m < T; m += NGW) {
        v4f v[8];
#pragma unroll
        for (int j = 0; j < 8; ++j) v[j] = ld4(X1, (size_t)m * D + 4 * lane + 256 * j, true) * ALPHA;
#pragma unroll
        for (int k = 0; k < 7; ++k) { size_t row;
            if (k == 0) row = (size_t)tsh * 256 + m;
            else { const unsigned s = __builtin_amdgcn_readfirstlane(SLOT[(size_t)m * 8 + (k - 1)]); const int e = (int)(s >> 16); row = (size_t)__builtin_amdgcn_readlane(toff, e) * 256 + (s & 0xffffu); }
#if YEXP_FP8
            const unsigned* yr = (const unsigned*)((const unsigned char*)YE + row * D) + lane;
#pragma unroll
            for (int j = 0; j < 8; ++j) { const unsigned y = yr[64 * j]; const auto lo = __builtin_amdgcn_cvt_pk_f32_fp8(y, false), hi = __builtin_amdgcn_cvt_pk_f32_fp8(y, true);
                v[j].x += lo[0] * (1.f / YSC); v[j].y += lo[1] * (1.f / YSC); v[j].z += hi[0] * (1.f / YSC); v[j].w += hi[1] * (1.f / YSC); } }
#else
            const v2u* yr = (const v2u*)(YE + row * D) + lane;
#pragma unroll
            for (int j = 0; j < 8; ++j) { const v2u y = yr[64 * j]; v[j].x += bflo(y.x); v[j].y += bfhi(y.x); v[j].z += bflo(y.y); v[j].w += bfhi(y.y); } }
#endif
        float s = 0.f;
#pragma unroll
        for (int j = 0; j < 8; ++j) s += (v[j].x + v[j].y) + (v[j].z + v[j].w);
        const float mean = wave_sum(s) * (1.f / D); float s2 = 0.f;
#pragma unroll
        for (int j = 0; j < 8; ++j) { v[j] = v[j] - mean; s2 += (v[j].x * v[j].x + v[j].y * v[j].y) + (v[j].z * v[j].z + v[j].w * v[j].w); }
        const float rstd = rsqrtf(wave_sum(s2) * (1.f / D) + LN_EPS);
#pragma unroll
        for (int j = 0; j < 8; ++j) { const v4f gg = ((const v4f*)g2)[lane + 64 * j], bb = ((const v4f*)b2)[lane + 64 * j]; const v4f o = v[j] * rstd * gg + bb;
            if (dbf) ((v2u*)((bf16*)dst + (size_t)m * D))[lane + 64 * j] = (v2u){pk2(o.x, o.y), pk2(o.z, o.w)};
            else ((v4f*)((float*)dst + (size_t)m * D))[lane + 64 * j] = o; }
    }
}

constexpr int NPH = 11;
template <class S> struct DupOrder {
    S s; int n;
    __device__ __forceinline__ bool next(int i, Unit& u) const { return s.next(i >= n ? i - n : i, u); }
    __device__ __forceinline__ int row_token(int i, int r) const { return s.row_token(i >= n ? i - n : i, r); }
    __device__ __forceinline__ void a_ready(const Unit& u) const { s.a_ready(u); }
    __device__ __forceinline__ void done(const Unit& u) const { s.done(u); }
};
template <class S> __device__ __forceinline__ int count_units(const S& s) { Unit u; int n = 0; while (n < 64 && s.next(n, u)) ++n; return n; }
#define ORDER_T(k, T) typename std::conditional<PROBE_DUP == (k), DupOrder<T>, T>::type
template <class S> __device__ __forceinline__ DupOrder<S> make_order(const S& s, std::true_type) { DupOrder<S> d{s, count_units(s)}; d.n = count_units(s); return d; }
template <class S> __device__ __forceinline__ S make_order(const S& s, std::false_type) { return s; }
#define MAKE_ORDER(k, s) make_order(s, std::integral_constant<bool, PROBE_DUP == (k)>())
template <int l>
__device__ __forceinline__ void run_layer(const Params& p, LAS unsigned char* lds, const XcdBarrier& bar, int tid, int lane, int wave, int G, int wg, int gw, int NGW) {
    unsigned char* ws = p.ws;
    {
        const void* xin = (l == 0) ? (const void*)p.in[I_X] : (const void*)(ws + WS_XCUR);
        void* xout = (l == NL - 1) ? (void*)p.out : (void*)(ws + WS_XCUR);
#ifndef PROBE_DUP
#define PROBE_DUP (-1)
#endif
#define IS_GEMM_PH(k) ((k) == 1 || (k) == 5 || (k) == 6 || (k) == 8 || (k) == 9)
#define REP(k) _Pragma("nounroll") for (int _r = 0; _r < ((PROBE_DUP == (k) && !IS_GEMM_PH(k)) ? 2 + (p.ph_lo >> 20) : 1); ++_r)
#ifndef PH_MASK
#define PH_MASK 0x7ff
#endif
#define RUN(k) (((PH_MASK >> (k)) & 1) && p.ph_lo <= l * NPH + (k) && l * NPH + (k) < p.ph_hi)
#define SEAM(k) do { if (l * NPH + (k) + 1 < p.ph_hi) xcd_barrier(bar); } while (0)
        if (RUN(0)) { REP(0) { phase_convert<0>(p, l, lds, gw, NGW, wave, lane);
#if defined(PROBE_CONV0)
            phase_convert<1>(p, l, lds, gw, NGW, wave, lane);
#endif
 phase_xprep(p, l, xin, l > 0, lds, gw, NGW, tid, lane); } SEAM(0); }
        if (RUN(1)) { REP(1) { pg8::Gemm g{(const bf16*)(ws + WS_XB), (const bf16*)(ws + WS_WIN), T, ZC, D / 2, D / 2, D / 2}; pg8::StaticOrder S; S.init(T, (GATE_SPLIT && G == 256) ? ZC_GATE : ZC, G, wg);
            pg8::EpiBf16<0> E{(bf16*)(ws + WS_Z), ZC, nullptr, 0, 0, 1.f / 64.f};
            auto S2 = MAKE_ORDER(1, S); pg8::gemm_phase<pg8::EpiBf16<0>, ORDER_T(1, pg8::StaticOrder), true, true, true>(lds, g, S2, E); } SEAM(1); }
        if (RUN(2)) { REP(2) { for (int it = wg; it < 1536; it += G) { if (it < 512) gdn_pre_item(p, l, lds, it, tid, wave, lane); else if (it < 1024) ml_pre_item(p, l, lds, it - 512, tid, wave, lane); else vt_item(p, lds, it - 1024, tid); } } SEAM(2); }
        if (RUN(3)) { REP(3) { phase_mixers(p, l, lds, wg, G, tid, wave, lane, bar); } SEAM(3); }
        if (RUN(4)) { REP(4) { phase_post(p, l, gw, NGW, lane); } SEAM(4); }
        if (RUN(5)) { REP(5) { constexpr int KM = MERGE_FP8 ? BRW / 2 : BRW; pg8::Gemm g{(const bf16*)(ws + WS_BR), (const bf16*)(ws + WS_WBR), T, D, KM, KM, KM}; pg8::StaticOrder S; S.init(T, D, G, wg);
            EpiMergeH E{(const bf16*)(ws + ((GATE_FP8 && GATE_SPLIT && G == 256) ? WS_MTMP : WS_Z)), (bf16*)(ws + WS_MSUM)};
            auto S2 = MAKE_ORDER(5, S); pg8::gemm_phase<EpiMergeH, ORDER_T(5, pg8::StaticOrder), true, true, MERGE_FP8 != 0>(lds, g, S2, E); } SEAM(5); }
        if (RUN(6)) { REP(6) { pg8::Gemm g{(const bf16*)(ws + WS_MSUM), (const bf16*)(ws + WS_WOUT), T, D, D / 2, D / 2, D / 2}; pg8::StaticOrder S; S.init(T, D, G, wg);
            EpiResid E{xin, (bf16*)(ws + WS_Y), 1.f / 64.f, l > 0};
            auto S2 = MAKE_ORDER(6, S); pg8::gemm_phase<EpiResid, ORDER_T(6, pg8::StaticOrder), true, true, true>(lds, g, S2, E); } SEAM(6); }
        if (RUN(7)) { REP(7) { phase_ln1_router(p, l, lds, wg, G, wave, lane, (PROBE_DUP == 7 && _r == 0) ? 16384 : 0); } SEAM(7); }
        if (RUN(8)) { REP(8) { const unsigned* cnt = (const unsigned*)(ws + WS_CTL) + CW_CNT + l * 4096; MoeTab M(lds); moe_tables(M, cnt, tid, lane, wave);
            const int wgx = (G % 8 == 0) ? (G / 8) * (wg & 7) + (wg >> 3) : wg;
            UpOrder S{M, 0}; S.n = up_order_build(M, (const int*)(ws + WS_LIST), (const float*)(ws + WS_WL), wgx, G, tid);
            constexpr int KU = MOE_UP_FP8 ? D / 2 : D;
            pg8::Gemm g{(const bf16*)(ws + WS_X1B), (const bf16*)(ws + WS_WUP), T, NEX * 1024, KU, KU, KU};
            EpiGluSparse E{(LAS const float*)M.wt, (bf16*)(ws + WS_HB)};
            auto S2 = MAKE_ORDER(8, S); pg8::gemm_phase_gather<EpiGluSparse, ORDER_T(8, UpOrder), MOE_UP_FP8 != 0>(lds, g, S2, E); } SEAM(8); }
        if (RUN(9)) { REP(9) { const unsigned* cnt = (const unsigned*)(ws + WS_CTL) + CW_CNT + l * 4096; MoeTab M(lds); moe_tables(M, cnt, tid, lane, wave);
            const int wgx = (G % 8 == 0) ? (G / 8) * (wg & 7) + (wg >> 3) : wg;
            DownOrder S{M, G, wgx, 8 * M.t[65]};
            constexpr int KD = MOE_DN_FP8 ? ED / 2 : ED;
            pg8::Gemm g{(const bf16*)(ws + WS_HB), (const bf16*)(ws + WS_WDN), HROWS, NEX * D, KD, KD, KD};
            EpiYexp E{(bf16*)(ws + WS_YEXP)};
            auto S2 = MAKE_ORDER(9, S); pg8::gemm_phase<EpiYexp, ORDER_T(9, DownOrder), true, true, MOE_DN_FP8 != 0>(lds, g, S2, E); } SEAM(9); }
        if (RUN(10)) { REP(10) { phase_combine_ln2(p, l, xout, l != NL - 1, gw, NGW, lane); } SEAM(10); }
#undef RUN
#undef SEAM
    }
}
__global__ void __launch_bounds__(512, 2) fwd_kernel(Params p) {
    extern __shared__ __attribute__((aligned(16))) unsigned char lds_raw[];
    LAS unsigned char* lds = (LAS unsigned char*)lds_raw;
    const int tid = threadIdx.x, lane = tid & 63, wave = __builtin_amdgcn_readfirstlane(tid >> 6);
    const int G = gridDim.x, wg = blockIdx.x, gw = wg * 8 + wave, NGW = G * 8;
    volatile LAS unsigned* MISC = (volatile LAS unsigned*)(lds + MISC_OFF);
    if (tid < 32) MISC[tid] = 0u;
    __syncthreads();
    unsigned* ctl = (unsigned*)(p.ws + WS_CTL);
    const bool multi = (p.ph_hi - p.ph_lo) > 1;
    XcdBarrier bar; bar.bar = ctl + CW_BAR; bar.x = 0; bar.st = nullptr;
    if (multi) bar = xcd_barrier_post(ctl + CW_BAR, MISC + 8);
    run_layer<0>(p, lds, bar, tid, lane, wave, G, wg, gw, NGW);
    run_layer<1>(p, lds, bar, tid, lane, wave, G, wg, gw, NGW);
}

#ifndef MK_MULTI_LAUNCH
#define MK_MULTI_LAUNCH 0
#endif
extern "C" void kernel_launch(void* const* d_in, const int* in_sizes, int n_in, void* d_out, int out_size, void* d_ws, size_t ws_size, hipStream_t stream) {
    static int grid = 0;
    if (grid == 0) {
        if (n_in != 27 || out_size != T * D || ws_size < WS_END) { fprintf(stderr, "kernel_launch: unexpected shapes (n_in %d out %d ws %zu need %zu)\n", n_in, out_size, ws_size, (size_t)WS_END); grid = -1; return; }
        int dev = 0, cus = 0, per_cu = 0;
        if (hipGetDevice(&dev) != hipSuccess || hipDeviceGetAttribute(&cus, hipDeviceAttributeMultiprocessorCount, dev) != hipSuccess) { grid = -1; return; }
        if (hipFuncSetAttribute((const void*)fwd_kernel, hipFuncAttributeMaxDynamicSharedMemorySize, LDS_BYTES) != hipSuccess) { fprintf(stderr, "kernel_launch: hipFuncSetAttribute failed\n"); grid = -1; return; }
        if (hipOccupancyMaxActiveBlocksPerMultiprocessor(&per_cu, (const void*)fwd_kernel, 512, LDS_BYTES) != hipSuccess || per_cu < 1) { fprintf(stderr, "kernel_launch: occupancy query says %d\n", per_cu); }
        (void)hipGetLastError();
        grid = cus;
        if (GATE_FP8 && GATE_SPLIT && cus != 256) { fprintf(stderr, "kernel_launch: this build's phase-3 role split assumes 256 CUs (have %d)\n", cus); grid = -1; return; }
    }
    if (grid < 0) return;
    (void)hipMemsetAsync((char*)d_ws + WS_CTL, 0, CTL_ZERO_BYTES, stream);
    Params p{};
    for (int i = 0; i < 27; ++i) p.in[i] = (const float*)d_in[i];
    p.out = (float*)d_out; p.ws = (unsigned char*)d_ws;
#if MK_MULTI_LAUNCH
    for (int ph = 0; ph < NL * NPH; ++ph) { p.ph_lo = ph; p.ph_hi = ph + 1; hipLaunchKernelGGL(fwd_kernel, dim3(grid), dim3(512), LDS_BYTES, stream, p); }
#else
    p.ph_lo = 0; p.ph_hi = NL * NPH; hipLaunchKernelGGL(fwd_kernel, dim3(grid), dim3(512), LDS_BYTES, stream, p);
#endif
}
```

```cpp
#include <hip/hip_runtime.h>
#include <cstdio>
#include <cstdint>
#include <type_traits>
namespace pg8 {
#define PG8_LAS __attribute__((address_space(3)))
typedef unsigned short bf16_t;
typedef short bf16x8 __attribute__((ext_vector_type(8)));
typedef float f32x4 __attribute__((ext_vector_type(4)));
typedef unsigned u32x4 __attribute__((ext_vector_type(4)));
constexpr int BM = 256, BK = 64, HALF = 128, HTB = HALF * BK * 2  , STAGE_BYTES = 8 * HTB, NXCD = 8, WGM = 8;

__host__ __device__ __forceinline__ int lds_byte(int r, int c) { const int st = (r >> 4) * 2 + (c >> 5), rr = r & 15, cc = c & 31, ob = rr * 64 + cc * 2; return st * 1024 + (ob ^ (((ob >> 9) & 1) << 5)); }
__host__ __device__ __forceinline__ void stage_rc(int b, int& R, int& C) { const int st = b / 1024, sb = b % 1024, swz = sb ^ (((sb >> 9) & 1) << 5); R = (st >> 1) * 16 + swz / 64; C = (st & 1) * 32 + (swz % 64) / 2; }
__host__ __device__ __forceinline__ int perm32(int rho) { const int n = rho >> 4, i = rho & 15; return 8 * (i >> 2) + 4 * n + (i & 3); }

struct Unit { int pm, pn, aux; };
struct Gemm { const bf16_t* A; const bf16_t* Bt; int M, N, K, lda, ldb; };

struct StaticOrder {
    int nM, nN, nwg, G, c;
    __host__ __device__ void init(int M, int N, int G_, int c_) { nM = M / BM; nN = N / BM; nwg = nM * nN; G = G_; c = c_; }
    __host__ __device__ bool next(int i, Unit& u) const {
        const long L = (long)i * G + c; if (L >= nwg) return false;
        int wgid = (int)L; { const int q = nwg / NXCD, r = nwg % NXCD, xcd = wgid % NXCD, off = wgid / NXCD; wgid = (xcd < r ? xcd * (q + 1) : r * (q + 1) + (xcd - r) * q) + off; }
        const int nig = WGM * nN, gid = wgid / nig, fm = gid * WGM, gsz = (nM - fm) < WGM ? (nM - fm) : WGM;
        u.pm = fm + ((wgid % nig) % gsz); u.pn = (wgid % nig) / gsz; return true;
    }
    __device__ __forceinline__ void a_ready(const Unit&) const {}
    __device__ __forceinline__ void done(const Unit&) const {}
};

__device__ __forceinline__ unsigned cvt_pk_bf16(float lo, float hi) { unsigned r; asm volatile("v_cvt_pk_bf16_f32 %0, %1, %2" : "=v"(r) : "v"(lo), "v"(hi)); return r; }
typedef float f32x2 __attribute__((ext_vector_type(2)));
__device__ __forceinline__ f32x2 gelu_pk(f32x2 v) {
    const f32x2 av = __builtin_elementwise_abs(v), d = av * 0.2316418882f + 1.0f;
    f32x2 t; t.x = __builtin_amdgcn_rcpf(d.x); t.y = __builtin_amdgcn_rcpf(d.y);
    f32x2 q = t * 0.5307027145f + (-0.7265760135f); q = q * t + 0.7107068705f; q = q * t + (-0.142248368f); q = q * t + 0.127414796f; q = q * t;
    const f32x2 s = (v * v) * (-0.72134752044f);
    f32x2 e; e.x = __builtin_amdgcn_exp2f(s.x); e.y = __builtin_amdgcn_exp2f(s.y);
    const f32x2 m = v * (q * e), r = v - m;
    f32x2 o; o.x = v.x < 0.f ? m.x : r.x; o.y = v.y < 0.f ? m.y : r.y; return o;
}

template <int ACT  > struct EpiBf16 {
    static constexpr bool PERM = true, AFTER_DRAIN = false; static constexpr int MID = 0; static_assert(ACT == 0 || ACT == 1, "EpiBf16: ACT is 0 (none) or 1 (gelu_pk)");
    bf16_t* O; int ldc; const float* bias; int split_cols; size_t split_stride; float scale0;
    __device__ __forceinline__ void operator()(const f32x4 (&acc)[2][2][4][2], const Unit& u, int wr, int wc, int fr, int fq) const {
        const int row0 = u.pm * BM + wr * 64 + fr; int colt = u.pn * BM; bf16_t* base = O;
        float sc = scale0; if (split_cols) { const int t = colt / split_cols; base += (size_t)t * split_stride; colt -= t * split_cols; if (t != 0) sc = 1.f; }
        const int col0 = colt + wc * 32 + 8 * fq, bcol0 = u.pn * BM + wc * 32 + 8 * fq;
        f32x4 bv[2][2];
#pragma unroll
        for (int bj = 0; bj < 2; ++bj)
#pragma unroll
            for (int n = 0; n < 2; ++n) bv[bj][n] = bias ? *(const f32x4*)(bias + bcol0 + bj * HALF + 4 * n) : (f32x4){0.f, 0.f, 0.f, 0.f};
#pragma unroll
        for (int ai = 0; ai < 2; ++ai)
#pragma unroll
            for (int m = 0; m < 4; ++m) { bf16_t* rowp = base + (size_t)(row0 + ai * HALF + m * 16) * ldc + col0;
#pragma unroll
                for (int bj = 0; bj < 2; ++bj) { f32x4 v0 = acc[ai][bj][m][0] + bv[bj][0], v1 = acc[ai][bj][m][1] + bv[bj][1];
                    if (ACT == 1) { f32x2 a = gelu_pk((f32x2){v0[0], v0[1]}), b = gelu_pk((f32x2){v0[2], v0[3]}), c = gelu_pk((f32x2){v1[0], v1[1]}), d = gelu_pk((f32x2){v1[2], v1[3]});
                        v0 = (f32x4){a.x, a.y, b.x, b.y}; v1 = (f32x4){c.x, c.y, d.x, d.y}; }
                    v0 = v0 * sc; v1 = v1 * sc; u32x4 w; w.x = cvt_pk_bf16(v0[0], v0[1]); w.y = cvt_pk_bf16(v0[2], v0[3]); w.z = cvt_pk_bf16(v1[0], v1[1]); w.w = cvt_pk_bf16(v1[2], v1[3]);
                    *(u32x4*)(rowp + bj * HALF) = w; } }
    }
};

typedef int i32x8 __attribute__((ext_vector_type(8)));
__device__ __forceinline__ i32x8 cat8(const bf16x8 a, const bf16x8 b) { typedef int i32x4 __attribute__((ext_vector_type(4))); const i32x4 x = __builtin_bit_cast(i32x4, a), y = __builtin_bit_cast(i32x4, b); return (i32x8){x[0], x[1], x[2], x[3], y[0], y[1], y[2], y[3]}; }
__device__ __forceinline__ bf16x8 lo8(const i32x8 v) { typedef int i32x4 __attribute__((ext_vector_type(4))); return __builtin_bit_cast(bf16x8, __builtin_shufflevector(v, v, 0, 1, 2, 3)); }
__device__ __forceinline__ bf16x8 hi8(const i32x8 v) { typedef int i32x4 __attribute__((ext_vector_type(4))); return __builtin_bit_cast(bf16x8, __builtin_shufflevector(v, v, 4, 5, 6, 7)); }
template <class Epi, class Sched, bool ALIGN_EPI = false, bool SP2 = false, bool FP8 = false>
__device__ __forceinline__ void gemm_phase(PG8_LAS unsigned char* lds, const Gemm g, const Sched& S, const Epi& E) {
    const int tid = threadIdx.x, wid = __builtin_amdgcn_readfirstlane(tid >> 6), lane = tid & 63, wr = wid >> 2, wc = wid & 3, fr = lane & 15, fq = lane >> 4;
    const int K = g.K, nt = K / BK;
    unsigned voffA[2], voffB[2];
#pragma unroll
    for (int i = 0; i < 2; ++i) { int R, C; stage_rc(tid * 16 + i * 8192, R, C); const int Rb = Epi::PERM ? ((R & ~31) + perm32(R & 31)) : R;
        voffA[i] = (unsigned)(R * g.lda + C) * 2u; voffB[i] = (unsigned)(Rb * g.ldb + C) * 2u; }
    const size_t kstep = (size_t)(BK * 2);
    const size_t hstepA = (size_t)HALF * g.lda * 2, hstepB = (size_t)HALF * g.ldb * 2;
    const size_t tstepA = 2 * hstepA, tstepB = 2 * hstepB;
    const unsigned ldsw = (unsigned)wid * 1024u;
    const int aoff = lds_byte(wr * 64 + fr, fq * 8), boff = lds_byte(wc * 32 + fr, fq * 8);
#define PG8_SA(b, h) (((b) * 2 + (h)) * HTB)
#define PG8_SB(b, h) ((4 + (b) * 2 + (h)) * HTB)
#define PG8_STAGE(bufoff, gbase, voff) do { _Pragma("unroll") for (int _i = 0; _i < 2; ++_i) \
        __builtin_amdgcn_global_load_lds((const unsigned*)((const char*)(gbase) + (voff)[_i]), (PG8_LAS unsigned*)(lds + (bufoff) + ldsw + _i * 8192), 16, 0, 0); } while (0)
#define PG8_LDA(dst, b, h) do { _Pragma("unroll") for (int m = 0; m < 4; ++m) { if constexpr (FP8) dst##8[m] = cat8(*(const PG8_LAS bf16x8*)(lds + PG8_SA(b, h) + aoff + m * 2048), *(const PG8_LAS bf16x8*)(lds + PG8_SA(b, h) + aoff + m * 2048 + 1024)); \
        else { _Pragma("unroll") for (int k = 0; k < 2; ++k) dst[m][k] = *(const PG8_LAS bf16x8*)(lds + PG8_SA(b, h) + aoff + m * 2048 + k * 1024); } } } while (0)
#define PG8_LDB(dst, b, h) do { _Pragma("unroll") for (int n = 0; n < 2; ++n) { if constexpr (FP8) dst##8[n] = cat8(*(const PG8_LAS bf16x8*)(lds + PG8_SB(b, h) + boff + n * 2048), *(const PG8_LAS bf16x8*)(lds + PG8_SB(b, h) + boff + n * 2048 + 1024)); \
        else { _Pragma("unroll") for (int k = 0; k < 2; ++k) dst[n][k] = *(const PG8_LAS bf16x8*)(lds + PG8_SB(b, h) + boff + n * 2048 + k * 1024); } } } while (0)
#define PG8_MMA(ai, bj, At, Bt) do { __builtin_amdgcn_s_setprio(1); _Pragma("unroll") for (int m = 0; m < 4; ++m) _Pragma("unroll") for (int n = 0; n < 2; ++n) { \
        if constexpr (FP8) asm volatile("v_mfma_scale_f32_16x16x128_f8f6f4 %0, %1, %2, %0, %3, %3 op_sel_hi:[0,0,0]" : "+v"(acc[ai][bj][m][n]) : "v"(Bt##8[n]), "v"(At##8[m]), "v"(fp8_unit_scale)); \
        else { _Pragma("unroll") for (int k = 0; k < 2; ++k) acc[ai][bj][m][n] = __builtin_amdgcn_mfma_f32_16x16x32_bf16(Bt[n][k], At[m][k], acc[ai][bj][m][n], 0, 0, 0); } } __builtin_amdgcn_s_setprio(0); } while (0)
#define PG8_WAIT_V(n) asm volatile("s_waitcnt vmcnt(" #n ")" ::: "memory")
#define PG8_WAIT_L(n) asm volatile("s_waitcnt lgkmcnt(" #n ")" ::: "memory")
#define PG8_BAR __builtin_amdgcn_s_barrier()
#define PG8_SCHED __builtin_amdgcn_sched_barrier(0)
    Unit cur, nxt; int ui = 0;
    if (!S.next(0, cur)) return;
    f32x4 acc[2][2][4][2];
#pragma unroll
    for (int a = 0; a < 2; ++a)
#pragma unroll
        for (int b = 0; b < 2; ++b)
#pragma unroll
            for (int m = 0; m < 4; ++m)
#pragma unroll
                for (int n = 0; n < 2; ++n) acc[a][b][m][n] = (f32x4){0.f, 0.f, 0.f, 0.f};
    int fp8_unit_scale = 0x7F7F7F7F; asm volatile("" : "+v"(fp8_unit_scale));
    bf16x8 At[4][2], B0[2][2], B1[2][2];
    i32x8 At8[4], B08[2], B18[2];
    const char* cA = (const char*)g.A + (size_t)cur.pm * tstepA; const char* cB = (const char*)g.Bt + (size_t)cur.pn * tstepB;
    S.a_ready(cur);
    if constexpr (SP2) {
        PG8_STAGE(PG8_SB(0, 0), cB, voffB); PG8_STAGE(PG8_SB(0, 1), cB + hstepB, voffB); PG8_STAGE(PG8_SA(0, 0), cA, voffA); PG8_STAGE(PG8_SA(0, 1), cA + hstepA, voffA);
        if (wr == 1) PG8_BAR;
        PG8_WAIT_V(2); PG8_BAR;
        PG8_STAGE(PG8_SB(1, 0), cB + kstep, voffB); PG8_STAGE(PG8_SA(1, 0), cA + kstep, voffA); PG8_STAGE(PG8_SB(1, 1), cB + hstepB + kstep, voffB);
        PG8_WAIT_V(6); PG8_BAR;
    } else {
        PG8_STAGE(PG8_SB(0, 0), cB, voffB); PG8_STAGE(PG8_SA(0, 0), cA, voffA); PG8_STAGE(PG8_SB(0, 1), cB + hstepB, voffB); PG8_STAGE(PG8_SA(0, 1), cA + hstepA, voffA);
        if (wr == 1) PG8_BAR;
        PG8_WAIT_V(4); PG8_BAR;
        PG8_STAGE(PG8_SB(1, 0), cB + kstep, voffB); PG8_STAGE(PG8_SA(1, 0), cA + kstep, voffA); PG8_STAGE(PG8_SB(1, 1), cB + hstepB + kstep, voffB);
        PG8_WAIT_V(6); PG8_BAR;
    }
    for (;;) {
        const bool has_next = S.next(ui + 1, nxt);
        const char* nA = has_next ? (const char*)g.A + (size_t)nxt.pm * tstepA : cA; const char* nB = has_next ? (const char*)g.Bt + (size_t)nxt.pn * tstepB : cB;
        for (int t = 0; t < nt; t += 2) {
            const bool last = (t == nt - 2);
            const char* a1 = cA + (size_t)(t + 1) * kstep;
            const char* a2 = last ? nA : cA + (size_t)(t + 2) * kstep; const char* b2 = last ? nB : cB + (size_t)(t + 2) * kstep;
            const char* a3 = a2 + kstep; const char* b3 = b2 + kstep;
            if (last && has_next) S.a_ready(nxt);
            if constexpr (SP2) {
            if constexpr (Epi::MID > 0) { if (t != 0 && (t % Epi::MID) == 0) { PG8_SCHED; if constexpr (FP8) asm volatile("s_nop 7\n\ts_nop 7" ::: "memory"); E.mid(acc, cur, t / Epi::MID, wr, wc, fr, fq); if constexpr (FP8) asm volatile("s_nop 7" ::: "memory"); PG8_SCHED; } }
            PG8_LDB(B0, 0, 0); PG8_LDB(B1, 0, 1); PG8_SCHED; PG8_LDA(At, 0, 0); PG8_STAGE(PG8_SA(1, 1), a1 + hstepA, voffA);
            PG8_WAIT_V(8); PG8_WAIT_L(0); PG8_BAR; PG8_MMA(0, 0, At, B0); PG8_MMA(0, 1, At, B1); PG8_BAR; PG8_SCHED;
            PG8_LDA(At, 0, 1); PG8_STAGE(PG8_SB(0, 0), b2, voffB); PG8_STAGE(PG8_SB(0, 1), b2 + hstepB, voffB); PG8_STAGE(PG8_SA(0, 0), a2, voffA);
            PG8_WAIT_V(8); PG8_WAIT_L(0); PG8_BAR; PG8_MMA(1, 0, At, B0); PG8_MMA(1, 1, At, B1); PG8_BAR; PG8_SCHED;
            PG8_LDB(B0, 1, 0); PG8_LDB(B1, 1, 1); PG8_SCHED; PG8_LDA(At, 1, 0); PG8_STAGE(PG8_SA(0, 1), a2 + hstepA, voffA);
            PG8_WAIT_V(8); PG8_WAIT_L(0); PG8_BAR; PG8_MMA(0, 0, At, B0); PG8_MMA(0, 1, At, B1); PG8_BAR; PG8_SCHED;
            PG8_LDA(At, 1, 1); PG8_STAGE(PG8_SB(1, 0), b3, voffB); PG8_STAGE(PG8_SB(1, 1), b3 + hstepB, voffB); PG8_STAGE(PG8_SA(1, 0), a3, voffA);
            PG8_WAIT_V(8); PG8_WAIT_L(0); PG8_BAR; PG8_MMA(1, 0, At, B0); PG8_MMA(1, 1, At, B1); PG8_BAR; PG8_SCHED;
            } else {
            PG8_LDB(B0, 0, 0); PG8_SCHED; PG8_LDA(At, 0, 0); PG8_STAGE(PG8_SA(1, 1), a1 + hstepA, voffA);
            PG8_WAIT_L(8); PG8_BAR; PG8_WAIT_L(0); PG8_MMA(0, 0, At, B0); PG8_BAR; PG8_SCHED;
            PG8_LDB(B1, 0, 1); PG8_STAGE(PG8_SB(0, 0), b2, voffB);
            PG8_BAR; PG8_WAIT_L(0); PG8_MMA(0, 1, At, B1); PG8_BAR;
            PG8_LDA(At, 0, 1); PG8_STAGE(PG8_SA(0, 0), a2, voffA);
            PG8_BAR; PG8_WAIT_L(0); PG8_MMA(1, 0, At, B0); PG8_BAR; PG8_SCHED;
            PG8_STAGE(PG8_SB(0, 1), b2 + hstepB, voffB);
            PG8_WAIT_V(6); PG8_BAR; PG8_MMA(1, 1, At, B1); PG8_BAR;
            PG8_LDB(B0, 1, 0); PG8_SCHED; PG8_LDA(At, 1, 0); PG8_STAGE(PG8_SA(0, 1), a2 + hstepA, voffA);
            PG8_WAIT_L(8); PG8_BAR; PG8_WAIT_L(0); PG8_MMA(0, 0, At, B0); PG8_BAR; PG8_SCHED;
            PG8_LDB(B1, 1, 1); PG8_STAGE(PG8_SB(1, 0), b3, voffB);
            PG8_BAR; PG8_WAIT_L(0); PG8_MMA(0, 1, At, B1); PG8_BAR;
            PG8_LDA(At, 1, 1); PG8_STAGE(PG8_SA(1, 0), a3, voffA);
            PG8_BAR; PG8_WAIT_L(0); PG8_MMA(1, 0, At, B0); PG8_BAR; PG8_SCHED;
            PG8_STAGE(PG8_SB(1, 1), b3 + hstepB, voffB);
            PG8_WAIT_V(6); PG8_BAR; PG8_MMA(1, 1, At, B1); PG8_BAR;
            }
        }
        if constexpr (ALIGN_EPI) { if (wr == 0) PG8_BAR; }
        if constexpr (FP8) asm volatile("s_nop 7\n\ts_nop 7" ::: "memory");
        if constexpr (!Epi::AFTER_DRAIN) { E(acc, cur, wr, wc, fr, fq); S.done(cur); }
        if (!has_next) break;
#pragma unroll
        for (int a = 0; a < 2; ++a)
#pragma unroll
            for (int b = 0; b < 2; ++b)
#pragma unroll
                for (int m = 0; m < 4; ++m)
#pragma unroll
                    for (int n = 0; n < 2; ++n) acc[a][b][m][n] = (f32x4){0.f, 0.f, 0.f, 0.f};
        cur = nxt; cA = nA; cB = nB; ++ui;
        if constexpr (ALIGN_EPI) { if (wr == 1) PG8_BAR; }
    }
    PG8_WAIT_V(0);
    if constexpr (!ALIGN_EPI) { if (wr == 0) PG8_BAR; }
    PG8_BAR;
    if constexpr (Epi::AFTER_DRAIN) { E.fused(acc, cur, wr, wc, fr, fq, lds, wid, lane); S.done(cur); }
#undef PG8_SA
#undef PG8_SB
#undef PG8_STAGE
#undef PG8_LDA
#undef PG8_LDB
#undef PG8_MMA
#undef PG8_WAIT_V
#undef PG8_WAIT_L
#undef PG8_BAR
#undef PG8_SCHED
}
template <class Epi, class Sched, bool FP8 = false>
__device__ __forceinline__ void gemm_phase_gather(PG8_LAS unsigned char* lds, const Gemm g, const Sched& S, const Epi& E) {
    const int tid = threadIdx.x, wid = __builtin_amdgcn_readfirstlane(tid >> 6), lane = tid & 63, wr = wid >> 2, wc = wid & 3, fr = lane & 15, fq = lane >> 4;
    const int K = g.K, nt = K / BK;
    unsigned voffB[2]; int RA[2], CA[2];
#pragma unroll
    for (int i = 0; i < 2; ++i) { int R, C; stage_rc(tid * 16 + i * 8192, R, C); const int Rb = Epi::PERM ? ((R & ~31) + perm32(R & 31)) : R;
        RA[i] = R; CA[i] = C; voffB[i] = (unsigned)(Rb * g.ldb + C) * 2u; }
    const size_t kstep = (size_t)(BK * 2);
    const size_t hstepB = (size_t)HALF * g.ldb * 2, tstepB = 2 * hstepB;
    const unsigned ldsw = (unsigned)wid * 1024u;
    const int aoff = lds_byte(wr * 64 + fr, fq * 8), boff = lds_byte(wc * 32 + fr, fq * 8);
#define PG8_SA(b, h) (((b) * 2 + (h)) * HTB)
#define PG8_SB(b, h) ((4 + (b) * 2 + (h)) * HTB)
#define PG8_STAGE(bufoff, gbase, voff) do { _Pragma("unroll") for (int _i = 0; _i < 2; ++_i) \
        __builtin_amdgcn_global_load_lds((const unsigned*)((const char*)(gbase) + (voff)[_i]), (PG8_LAS unsigned*)(lds + (bufoff) + ldsw + _i * 8192), 16, 0, 0); } while (0)
#define PG8_LDA(dst, b, h) do { _Pragma("unroll") for (int m = 0; m < 4; ++m) { if constexpr (FP8) dst##8[m] = cat8(*(const PG8_LAS bf16x8*)(lds + PG8_SA(b, h) + aoff + m * 2048), *(const PG8_LAS bf16x8*)(lds + PG8_SA(b, h) + aoff + m * 2048 + 1024)); \
        else { _Pragma("unroll") for (int k = 0; k < 2; ++k) dst[m][k] = *(const PG8_LAS bf16x8*)(lds + PG8_SA(b, h) + aoff + m * 2048 + k * 1024); } } } while (0)
#define PG8_LDB(dst, b, h) do { _Pragma("unroll") for (int n = 0; n < 2; ++n) { if constexpr (FP8) dst##8[n] = cat8(*(const PG8_LAS bf16x8*)(lds + PG8_SB(b, h) + boff + n * 2048), *(const PG8_LAS bf16x8*)(lds + PG8_SB(b, h) + boff + n * 2048 + 1024)); \
        else { _Pragma("unroll") for (int k = 0; k < 2; ++k) dst[n][k] = *(const PG8_LAS bf16x8*)(lds + PG8_SB(b, h) + boff + n * 2048 + k * 1024); } } } while (0)
#define PG8_MMA(ai, bj, At, Bt) do { __builtin_amdgcn_s_setprio(1); _Pragma("unroll") for (int m = 0; m < 4; ++m) _Pragma("unroll") for (int n = 0; n < 2; ++n) { \
        if constexpr (FP8) asm volatile("v_mfma_scale_f32_16x16x128_f8f6f4 %0, %1, %2, %0, %3, %3 op_sel_hi:[0,0,0]" : "+v"(acc[ai][bj][m][n]) : "v"(Bt##8[n]), "v"(At##8[m]), "v"(fp8_unit_scale)); \
        else { _Pragma("unroll") for (int k = 0; k < 2; ++k) acc[ai][bj][m][n] = __builtin_amdgcn_mfma_f32_16x16x32_bf16(Bt[n][k], At[m][k], acc[ai][bj][m][n], 0, 0, 0); } } __builtin_amdgcn_s_setprio(0); } while (0)
#define PG8_WAIT_V(n) asm volatile("s_waitcnt vmcnt(" #n ")" ::: "memory")
#define PG8_WAIT_L(n) asm volatile("s_waitcnt lgkmcnt(" #n ")" ::: "memory")
#define PG8_BAR __builtin_amdgcn_s_barrier()
#define PG8_SCHED __builtin_amdgcn_sched_barrier(0)
#define PG8_ROWS(dst, ui_) do { _Pragma("unroll") for (int _h = 0; _h < 2; ++_h) _Pragma("unroll") for (int _i = 0; _i < 2; ++_i) \
        dst[_h][_i] = (unsigned)S.row_token((ui_), _h * HALF + RA[_i]) * (unsigned)(g.lda * 2) + (unsigned)(CA[_i] * 2); } while (0)
    Unit cur, nxt; int ui = 0;
    if (!S.next(0, cur)) return;
    f32x4 acc[2][2][4][2];
#pragma unroll
    for (int a = 0; a < 2; ++a)
#pragma unroll
        for (int b = 0; b < 2; ++b)
#pragma unroll
            for (int m = 0; m < 4; ++m)
#pragma unroll
                for (int n = 0; n < 2; ++n) acc[a][b][m][n] = (f32x4){0.f, 0.f, 0.f, 0.f};
    int fp8_unit_scale = 0x7F7F7F7F; asm volatile("" : "+v"(fp8_unit_scale));
    bf16x8 At[4][2], B0[2][2], B1[2][2];
    i32x8 At8[4], B08[2], B18[2];
    unsigned offC[2][2];
    PG8_ROWS(offC, 0);
    const char* gA = (const char*)g.A;
    const char* cB = (const char*)g.Bt + (size_t)cur.pn * tstepB;
    PG8_STAGE(PG8_SB(0, 0), cB, voffB); PG8_STAGE(PG8_SB(0, 1), cB + hstepB, voffB); PG8_STAGE(PG8_SA(0, 0), gA, offC[0]); PG8_STAGE(PG8_SA(0, 1), gA, offC[1]);
    if (wr == 1) PG8_BAR;
    PG8_WAIT_V(2); PG8_BAR;
    PG8_STAGE(PG8_SB(1, 0), cB + kstep, voffB); PG8_STAGE(PG8_SA(1, 0), gA + kstep, offC[0]); PG8_STAGE(PG8_SB(1, 1), cB + hstepB + kstep, voffB);
    PG8_WAIT_V(6); PG8_BAR;
    for (;;) {
        const bool has_next = S.next(ui + 1, nxt);
        const char* nB = has_next ? (const char*)g.Bt + (size_t)nxt.pn * tstepB : cB;
        for (int t = 0; t < nt; t += 2) {
            const bool last = (t == nt - 2);
            const char* a1 = gA + (size_t)(t + 1) * kstep;
            const char* a2 = last ? gA : gA + (size_t)(t + 2) * kstep; const char* b2 = last ? nB : cB + (size_t)(t + 2) * kstep;
            const char* a3 = a2 + kstep; const char* b3 = b2 + kstep;
            PG8_LDB(B0, 0, 0); PG8_LDB(B1, 0, 1); PG8_SCHED; PG8_LDA(At, 0, 0); PG8_STAGE(PG8_SA(1, 1), a1, offC[1]);
            if (last && has_next) { PG8_ROWS(offC, ui + 1); }
            PG8_WAIT_V(8); PG8_WAIT_L(0); PG8_BAR; PG8_MMA(0, 0, At, B0); PG8_MMA(0, 1, At, B1); PG8_BAR; PG8_SCHED;
            PG8_LDA(At, 0, 1); PG8_STAGE(PG8_SB(0, 0), b2, voffB); PG8_STAGE(PG8_SB(0, 1), b2 + hstepB, voffB); PG8_STAGE(PG8_SA(0, 0), a2, offC[0]);
            PG8_WAIT_V(8); PG8_WAIT_L(0); PG8_BAR; PG8_MMA(1, 0, At, B0); PG8_MMA(1, 1, At, B1); PG8_BAR; PG8_SCHED;
            PG8_LDB(B0, 1, 0); PG8_LDB(B1, 1, 1); PG8_SCHED; PG8_LDA(At, 1, 0); PG8_STAGE(PG8_SA(0, 1), a2, offC[1]);
            PG8_WAIT_V(8); PG8_WAIT_L(0); PG8_BAR; PG8_MMA(0, 0, At, B0); PG8_MMA(0, 1, At, B1); PG8_BAR; PG8_SCHED;
            PG8_LDA(At, 1, 1); PG8_STAGE(PG8_SB(1, 0), b3, voffB); PG8_STAGE(PG8_SB(1, 1), b3 + hstepB, voffB); PG8_STAGE(PG8_SA(1, 0), a3, offC[0]);
            PG8_WAIT_V(8); PG8_WAIT_L(0); PG8_BAR; PG8_MMA(1, 0, At, B0); PG8_MMA(1, 1, At, B1); PG8_BAR; PG8_SCHED;
        }
        if (wr == 0) PG8_BAR;
        if constexpr (FP8) asm volatile("s_nop 7\n\ts_nop 7" ::: "memory");
        E(acc, cur, wr, wc, fr, fq); S.done(cur);
        if (!has_next) break;
#pragma unroll
        for (int a = 0; a < 2; ++a)
#pragma unroll
            for (int b = 0; b < 2; ++b)
#pragma unroll
                for (int m = 0; m < 4; ++m)
#pragma unroll
                    for (int n = 0; n < 2; ++n) acc[a][b][m][n] = (f32x4){0.f, 0.f, 0.f, 0.f};
        cur = nxt; cB = nB; ++ui;
        if (wr == 1) PG8_BAR;
    }
    PG8_WAIT_V(0);
    PG8_BAR;
#undef PG8_ROWS
#undef PG8_SA
#undef PG8_SB
#undef PG8_STAGE
#undef PG8_LDA
#undef PG8_LDB
#undef PG8_MMA
#undef PG8_WAIT_V
#undef PG8_WAIT_L
#undef PG8_BAR
#undef PG8_SCHED
}
}

#ifndef GATE_FP8
#define GATE_FP8 1
#endif
#ifndef GATE_SPLIT
#define GATE_SPLIT 1
#endif
#ifndef YEXP_FP8
#define YEXP_FP8 1
#endif
#ifndef CONV_SKIP
#define CONV_SKIP 6
#endif
#ifndef MERGE_FP8
#define MERGE_FP8 1
#endif
#ifndef MOE_DN_FP8
#define MOE_DN_FP8 1
#endif
#ifndef MOE_UP_FP8
#define MOE_UP_FP8 1
#endif
#ifndef PROBE_NOATOM
#define PROBE_NOATOM 0
#endif
constexpr int T = 8192, D = 2048, NL = 2, BW = 512, ZC = 14336, INC = 14352;
constexpr int NE = 64, NEX = 65  , ED = 512;
constexpr int BRW = 4 * BW;
constexpr int HK = NEX * ED;
constexpr float ALPHA = 1.41421356237f;
constexpr float LN_EPS = 1e-5f;
constexpr float UPSC = MOE_UP_FP8 ? (1.f / 64.f) : 1.f;
constexpr float BRSC = MERGE_FP8 ? 8.f : 1.f, MGSC = MERGE_FP8 ? (1.f / (8.f * 64.f)) : 1.f;
constexpr float GSC = 8.f;
constexpr float YSC = 64.f;
constexpr float HSC = 8.f, DNSC = MOE_DN_FP8 ? (1.f / (HSC * 64.f)) : 1.f;
constexpr int ZC_SBQ = 0, ZC_SBK = 512, ZC_SBV = 1024, ZC_GMU = 1536, ZC_GMV = 2048, ZC_GDN = 2560, ZC_GDNG = 4096,
              ZC_MLQ = 4608, ZC_MLK = 4864, ZC_MLV = 5120, ZC_MLO = 5632, ZC_GATE = 6144;

#define GAS __attribute__((address_space(1)))
#define LAS __attribute__((address_space(3)))
typedef unsigned short bf16;
typedef unsigned v4u __attribute__((ext_vector_type(4)));
typedef unsigned v2u __attribute__((ext_vector_type(2)));
typedef float v4f __attribute__((ext_vector_type(4)));
typedef float v2f __attribute__((ext_vector_type(2)));
#define LDS_WAIT() asm volatile("s_waitcnt lgkmcnt(0)" ::: "memory")
#define LDS_BAR() do { asm volatile("s_waitcnt lgkmcnt(0)" ::: "memory"); __builtin_amdgcn_s_barrier(); asm volatile("" ::: "memory"); } while (0)

constexpr size_t MiB = 1u << 20;
constexpr size_t WS_CTL = 0, CTL_ZERO_BYTES = 1 * MiB;
constexpr size_t WS_WIN = 2 * MiB, WS_WBR = 58 * MiB, WS_WOUT = 66 * MiB, WS_WUP = 74 * MiB, WS_WDN = 334 * MiB;
constexpr size_t WS_XB = 464 * MiB, WS_SMALL = 496 * MiB, WS_EG = 497 * MiB, WS_BETA = WS_EG + 256 * 1024, WS_COMB = 498 * MiB;
constexpr size_t WS_Z = 500 * MiB, WS_GQ = 724 * MiB, WS_GK = 740 * MiB, WS_GV = 756 * MiB, WS_GO = 772 * MiB, WS_HO = 788 * MiB;
constexpr size_t WS_BR = 804 * MiB, WS_MTMP = 836 * MiB, WS_MSUM = 900 * MiB, WS_Y = 932 * MiB, WS_X1 = 996 * MiB, WS_X1B = 1060 * MiB;
constexpr size_t WS_XCUR = 1092 * MiB, WS_HB = 1156 * MiB, WS_YEXP = 1236 * MiB, WS_LIST = 1524 * MiB, WS_WL = 1526 * MiB, WS_SLOT = 1528 * MiB, WS_MQ = 1530 * MiB, WS_MS = 1534 * MiB, WS_MK = 1538 * MiB, WS_MV = 1542 * MiB, WS_MFL = 1552 * MiB, WS_HDEN = WS_MFL + 65536, WS_VT = 1553 * MiB, WS_END = 1561 * MiB;
constexpr size_t WS_GU = WS_GQ, WS_GNW = WS_GK, WS_GQG = WS_GK + 8 * MiB, WS_GKT = WS_GV, WS_GAT = WS_GV + 8 * MiB, WS_GDL = WS_GV + 12 * MiB;
constexpr int HROWS = 73728;
static_assert(WS_HB + (size_t)HROWS * ED * 2 <= WS_YEXP && WS_YEXP + (size_t)HROWS * D * 2 <= WS_LIST, "ws map (moe)");
static_assert(WS_WIN + (size_t)ZC * D * 2 <= WS_WBR && WS_WUP + (size_t)NEX * 1024 * D * 2 <= WS_WDN && WS_WDN + (size_t)D * HK * 2 <= WS_XB, "ws map (weights)");
static_assert(WS_Z + (size_t)T * ZC * 2 <= WS_GQ, "ws map (acts)");
constexpr int CW_BAR = 4096, CW_CNT = 16384;
constexpr int TAB_OFF = 131072 + 1024;
constexpr int LDS_BYTES = 163840, MISC_OFF = 131072 + 320;

__device__ __forceinline__ float bflo(unsigned w) { return __uint_as_float(w << 16); }
__device__ __forceinline__ float bfhi(unsigned w) { return __uint_as_float(w & 0xffff0000u); }
__device__ __forceinline__ unsigned f2bf(float f) { unsigned u = __float_as_uint(f); return (u + 0x7fffu + ((u >> 16) & 1u)) >> 16; }
typedef __bf16 bf16n2 __attribute__((ext_vector_type(2))); typedef float f32n2 __attribute__((ext_vector_type(2)));
__device__ __forceinline__ unsigned pk2(float lo, float hi) { const bf16n2 v = __builtin_convertvector((f32n2){lo, hi}, bf16n2); return __builtin_bit_cast(unsigned, v); }
__device__ __forceinline__ unsigned pk4_f8(float a, float b, float c, float d, float sc) {
    a = __builtin_amdgcn_fmed3f(a * sc, -448.f, 448.f); b = __builtin_amdgcn_fmed3f(b * sc, -448.f, 448.f); c = __builtin_amdgcn_fmed3f(c * sc, -448.f, 448.f); d = __builtin_amdgcn_fmed3f(d * sc, -448.f, 448.f);
    unsigned w = 0; w = __builtin_amdgcn_cvt_pk_fp8_f32(a, b, w, false); w = __builtin_amdgcn_cvt_pk_fp8_f32(c, d, w, true); return w; }
__device__ __forceinline__ v4f ld4(const void* base, size_t idx, bool is_bf16) {
    if (is_bf16) { const v2u r = *(const v2u*)((const unsigned short*)base + idx); return (v4f){bflo(r.x), bfhi(r.x), bflo(r.y), bfhi(r.y)}; }
    return *(const v4f*)((const float*)base + idx); }
__device__ __forceinline__ v4f ld4_nt(const void* base, size_t idx, bool is_bf16) {
    if (is_bf16) { const v2u r = __builtin_nontemporal_load((const v2u*)((const unsigned short*)base + idx)); return (v4f){bflo(r.x), bfhi(r.x), bflo(r.y), bfhi(r.y)}; }
    return __builtin_nontemporal_load((const v4f*)((const float*)base + idx)); }
template <int CTRL> __device__ __forceinline__ float dpp(float x) { return __builtin_bit_cast(float, __builtin_amdgcn_mov_dpp(__builtin_bit_cast(int, x), CTRL, 0xf, 0xf, true)); }
__device__ __forceinline__ float sum4(float x) { x += dpp<0xB1>(x); x += dpp<0x4E>(x); return x; }
__device__ __forceinline__ float sum8(float x) { x = sum4(x); x += dpp<0x141>(x); return x; }
__device__ __forceinline__ float sum16(float x) { x = sum8(x); x += dpp<0x140>(x); return x; }
__device__ __forceinline__ float wave_sum(float x) { x = sum16(x); x += __shfl_xor(x, 16); x += __shfl_xor(x, 32); return x; }
__device__ __forceinline__ float max8(float x) { x = fmaxf(x, dpp<0xB1>(x)); x = fmaxf(x, dpp<0x4E>(x)); x = fmaxf(x, dpp<0x141>(x)); return x; }
__device__ __forceinline__ float min8(float x) { x = fminf(x, dpp<0xB1>(x)); x = fminf(x, dpp<0x4E>(x)); x = fminf(x, dpp<0x141>(x)); return x; }
__device__ __forceinline__ float wave_scan_incl(float v) {
    v += __builtin_bit_cast(float, __builtin_amdgcn_update_dpp(0, __builtin_bit_cast(int, v), 0x111, 0xf, 0xf, true));
    v += __builtin_bit_cast(float, __builtin_amdgcn_update_dpp(0, __builtin_bit_cast(int, v), 0x112, 0xf, 0xf, true));
    v += __builtin_bit_cast(float, __builtin_amdgcn_update_dpp(0, __builtin_bit_cast(int, v), 0x114, 0xf, 0xf, true));
    v += __builtin_bit_cast(float, __builtin_amdgcn_update_dpp(0, __builtin_bit_cast(int, v), 0x118, 0xf, 0xf, true));
    v += __builtin_bit_cast(float, __builtin_amdgcn_update_dpp(0, __builtin_bit_cast(int, v), 0x142, 0xa, 0xf, false));
    v += __builtin_bit_cast(float, __builtin_amdgcn_update_dpp(0, __builtin_bit_cast(int, v), 0x143, 0xc, 0xf, false));
    return v;
}
__device__ __forceinline__ float sigmoidf_(float x) { return __builtin_amdgcn_rcpf(1.f + __expf(-x)); }
__device__ __forceinline__ float sigmoid_div(float x) { return 1.f / (1.f + __expf(-x)); }
__device__ __forceinline__ float siluf_(float x) { return x * __builtin_amdgcn_rcpf(1.f + __expf(-x)); }
__device__ __forceinline__ float softplusf_(float x) { return fmaxf(x, 0.f) + __logf(1.f + __expf(-fabsf(x))); }
__device__ __forceinline__ float gelu_tanh(float x) { const float y = 0.7978845608f * (x + 0.044715f * x * x * x); const float t = 1.f - 2.f * __builtin_amdgcn_rcpf(__expf(2.f * y) + 1.f); return 0.5f * x * (1.f + t); }
__device__ __forceinline__ void unpack8(const v4u r, float (&f)[8]) { f[0] = bflo(r.x); f[1] = bfhi(r.x); f[2] = bflo(r.y); f[3] = bfhi(r.y); f[4] = bflo(r.z); f[5] = bfhi(r.z); f[6] = bflo(r.w); f[7] = bfhi(r.w); }
#define XB_TMO      128
#define XB_XCNT(j)  (256  + 64 * (j))
#define XB_XSUB(j)  (1280 + 64 * (j))
#define XB_XGEN(j)  (2304 + 64 * (j))
#define XB_TOP      3328
#define XB_TOPGEN   3392
#define XCD_BAR_WORDS 3456
#define XB_SPIN_CAP (1u << 18)

__device__ __forceinline__ unsigned xb_ld(unsigned* p)              { return __hip_atomic_load(p, __ATOMIC_RELAXED, __HIP_MEMORY_SCOPE_AGENT); }
__device__ __forceinline__ unsigned xb_add(unsigned* p, unsigned v) { return __hip_atomic_fetch_add(p, v, __ATOMIC_RELAXED, __HIP_MEMORY_SCOPE_AGENT); }
__device__ __forceinline__ unsigned xb_xcc_id() { return (unsigned)__builtin_amdgcn_s_getreg((3 << 11) | 20) & 0xFu; }
#define XB_SPIN(cond, bar) do { unsigned _sp = 0; while (cond) { __builtin_amdgcn_s_sleep(1); \
    if ((++_sp & 255u) == 0u) { if (xb_ld(&(bar)[XB_TMO])) break; if (_sp > XB_SPIN_CAP) { atomicAdd(&(bar)[XB_TMO], 1u); break; } } } } while (0)

struct XcdBarrier {
    unsigned* bar; unsigned x;
    volatile LAS unsigned* st;
};

__device__ __forceinline__ XcdBarrier xcd_barrier_post(unsigned* bar, volatile LAS unsigned* st) {
    XcdBarrier b; b.bar = bar; b.x = xb_xcc_id(); b.st = st;
    if (threadIdx.x == 0) (void)xb_add(&bar[XB_XCNT(b.x)], 1u);
    return b;
}
__device__ __forceinline__ void xcd_barrier_complete(unsigned* bar, unsigned x, unsigned& nloc, unsigned& nx) {
    const unsigned G = gridDim.x * gridDim.y * gridDim.z;
    unsigned sum, cnt, mine, sp = 0u;
    for (;;) {
        sum = 0u; cnt = 0u; mine = 0u;
#pragma unroll
        for (unsigned j = 0; j < 16; ++j) { const unsigned c = xb_ld(&bar[XB_XCNT(j)]); sum += c; cnt += (c > 0u) ? 1u : 0u; mine = (j == x) ? c : mine; }
        if (sum == G) break;
        __builtin_amdgcn_s_sleep(1);
        if ((++sp & 255u) == 0u) { if (xb_ld(&bar[XB_TMO])) break; if (sp > XB_SPIN_CAP) { atomicAdd(&bar[XB_TMO], 1u); break; } }
    }
    nloc = mine > 0u ? mine : 1u; nx = cnt > 0u ? cnt : 1u;
}

__device__ __forceinline__ void xcd_barrier(const XcdBarrier& b) {
    asm volatile("s_waitcnt vmcnt(0)" ::: "memory");
    __syncthreads();
    if (threadIdx.x == 0) {
        unsigned* bar = b.bar;
        __builtin_amdgcn_s_waitcnt(0);
        unsigned nloc = b.st[0], nx = b.st[1];
        if (nloc == 0u) { xcd_barrier_complete(bar, b.x, nloc, nx); b.st[0] = nloc; b.st[1] = nx; }
        const unsigned old = xb_add(&bar[XB_XSUB(b.x)], 1u);
        const unsigned gen = old / nloc;
        if (old + 1u == (gen + 1u) * nloc) {
            __builtin_amdgcn_fence(__ATOMIC_RELEASE, "agent");
            asm volatile("s_waitcnt vmcnt(0)" ::: "memory");
            const unsigned og = xb_add(&bar[XB_TOP], 1u);
            const unsigned tg = og / nx;
            if (og + 1u == (tg + 1u) * nx) xb_add(&bar[XB_TOPGEN], 1u);
            else XB_SPIN(xb_ld(&bar[XB_TOPGEN]) == tg, bar);
            __builtin_amdgcn_fence(__ATOMIC_ACQUIRE, "agent");
            xb_add(&bar[XB_XGEN(b.x)], 1u);
            asm volatile("s_waitcnt vmcnt(0)" ::: "memory");
        } else {
            XB_SPIN(xb_ld(&bar[XB_XGEN(b.x)]) == gen, bar);
            __builtin_amdgcn_fence(__ATOMIC_ACQUIRE, "agent");
            asm volatile("s_waitcnt vmcnt(0)" ::: "memory");
        }
    }
    __syncthreads();
}

struct Params { const float* in[27]; float* out; unsigned char* ws; int ph_lo, ph_hi; };
enum { I_X = 0, I_WIN, I_GMNG, I_GMNB, I_GMWS, I_GMBS, I_CONVW, I_ALOG, I_DTB, I_GDNNG, I_MLIB, I_MLFB, I_MLNG, I_WBR, I_WOUT, I_LN1G, I_LN1B,
       I_WR, I_RB, I_WG, I_WU, I_WD, I_SG, I_SU, I_SD, I_LN2G, I_LN2B };

using pg8::f32x4; using pg8::u32x4; using pg8::Unit; using pg8::HALF; using pg8::BM;

struct EpiGate8 {
    static constexpr bool PERM = true, AFTER_DRAIN = false; static constexpr int MID = 0;
    unsigned char* ZG; float sc;
    __device__ __forceinline__ void operator()(const f32x4 (&acc)[2][2][4][2], const Unit& u, int wr, int wc, int fr, int fq) const {
        const int row0 = u.pm * BM + wr * 64 + fr, col0 = u.pn * BM - ZC_GATE + wc * 32 + 8 * fq; const float k = sc * GSC;
#pragma unroll
        for (int ai = 0; ai < 2; ++ai)
#pragma unroll
            for (int m = 0; m < 4; ++m)
#pragma unroll
                for (int bj = 0; bj < 2; ++bj) { const f32x4 v0 = acc[ai][bj][m][0], v1 = acc[ai][bj][m][1];
                    *(v2u*)(ZG + (size_t)(row0 + ai * HALF + m * 16) * (4 * D) + col0 + bj * HALF) = (v2u){pk4_f8(v0[0], v0[1], v0[2], v0[3], k), pk4_f8(v1[0], v1[1], v1[2], v1[3], k)}; }
    }
};
struct EpiMergeH {
    static constexpr bool PERM = true, AFTER_DRAIN = false; static constexpr int MID = MERGE_FP8 ? BW / (2 * pg8::BK) : BW / pg8::BK;
    const bf16* Z; bf16* msum;
    __device__ __forceinline__ void mid(f32x4 (&acc)[2][2][4][2], const Unit& u, int j, int wr, int wc, int fr, int fq) const {
        int row0 = u.pm * BM + wr * 64 + fr; const int col0 = u.pn * BM + wc * 32 + 8 * fq; asm volatile("" : "+v"(row0));
#if GATE_FP8
        const unsigned char* zp = (const unsigned char*)Z + (size_t)(j - 1) * D + col0;
#else
        const bf16* zp = Z + ZC_GATE + (size_t)(j - 1) * D + col0;
#endif
#if GATE_FP8
        v2u ga[2][2][2], gb[2][2][2];
#else
        v4u ga[2][2][2], gb[2][2][2];
#endif
#if GATE_FP8
#define MH_LD1(buf, m, bj, ai_, m0_) do { const unsigned char* q = zp + (size_t)(row0 + ai_ * HALF + (m0_ + m) * 16) * (4 * D) + bj * HALF; ga[buf][m][bj] = *(const v2u*)q; gb[buf][m][bj] = *(const v2u*)(q + D); } while (0)
#define MH_UNPK(w, f) do { const auto _l0 = __builtin_amdgcn_cvt_pk_f32_fp8(w.x, false), _h0 = __builtin_amdgcn_cvt_pk_f32_fp8(w.x, true), _l1 = __builtin_amdgcn_cvt_pk_f32_fp8(w.y, false), _h1 = __builtin_amdgcn_cvt_pk_f32_fp8(w.y, true); \
        f[0] = _l0[0] * (1.f / GSC); f[1] = _l0[1] * (1.f / GSC); f[2] = _h0[0] * (1.f / GSC); f[3] = _h0[1] * (1.f / GSC); f[4] = _l1[0] * (1.f / GSC); f[5] = _l1[1] * (1.f / GSC); f[6] = _h1[0] * (1.f / GSC); f[7] = _h1[1] * (1.f / GSC); } while (0)
#else
#define MH_LD1(buf, m, bj, ai_, m0_) do { const bf16* q = zp + (size_t)(row0 + ai_ * HALF + (m0_ + m) * 16) * ZC + bj * HALF; ga[buf][m][bj] = *(const v4u*)q; gb[buf][m][bj] = *(const v4u*)(q + D); } while (0)
#define MH_UNPK(w, f) unpack8(w, f)
#endif
#define MH_LOAD(buf, am_) do { const int ai_ = (am_) >> 1, m0_ = ((am_) & 1) * 2; _Pragma("unroll") for (int m = 0; m < 2; ++m) _Pragma("unroll") for (int bj = 0; bj < 2; ++bj) { \
            MH_LD1(buf, m, bj, ai_, m0_); } } while (0)
#define MH_APPLY(buf, am_) do { const int ai_ = (am_) >> 1, m0_ = ((am_) & 1) * 2; _Pragma("unroll") for (int m = 0; m < 2; ++m) _Pragma("unroll") for (int bj = 0; bj < 2; ++bj) { float a[8], b[8]; MH_UNPK(ga[buf][m][bj], a); MH_UNPK(gb[buf][m][bj], b); \
            _Pragma("unroll") for (int i = 0; i < 8; ++i) { const float ea = __builtin_amdgcn_exp2f(fmaxf(a[i], -60.f) * -1.44269504f), eb = __builtin_amdgcn_exp2f(fmaxf(b[i], -60.f) * -1.44269504f); \
                acc[ai_][bj][m0_ + m][i >> 2][i & 3] *= (1.f + eb) * __builtin_amdgcn_rcpf(1.f + ea); } } } while (0)
        MH_LOAD(0, 0); MH_LOAD(1, 1); asm volatile("" ::: "memory");
        MH_APPLY(0, 0); asm volatile("" ::: "memory"); MH_LOAD(0, 2); asm volatile("" ::: "memory");
        MH_APPLY(1, 1); asm volatile("" ::: "memory"); MH_LOAD(1, 3); asm volatile("" ::: "memory");
        MH_APPLY(0, 2); asm volatile("" ::: "memory");
        MH_APPLY(1, 3); asm volatile("" ::: "memory");
#undef MH_LOAD
#undef MH_APPLY
#undef MH_LD1
    }
    __device__ __forceinline__ void operator()(const f32x4 (&acc)[2][2][4][2], const Unit& u, int wr, int wc, int fr, int fq) const {
        const int row0 = u.pm * BM + wr * 64 + fr, col0 = u.pn * BM + wc * 32 + 8 * fq;
#pragma unroll
#if GATE_FP8
        for (int ai = 0; ai < 2; ++ai) { v2u gg[4][2];
#pragma unroll
            for (int m = 0; m < 4; ++m)
#pragma unroll
                for (int bj = 0; bj < 2; ++bj) gg[m][bj] = *(const v2u*)((const unsigned char*)Z + (size_t)(row0 + ai * HALF + m * 16) * (4 * D) + 3 * D + col0 + bj * HALF);
#else
        for (int ai = 0; ai < 2; ++ai) { v4u gg[4][2];
#pragma unroll
            for (int m = 0; m < 4; ++m)
#pragma unroll
                for (int bj = 0; bj < 2; ++bj) gg[m][bj] = *(const v4u*)(Z + (size_t)(row0 + ai * HALF + m * 16) * ZC + ZC_GATE + 3 * D + col0 + bj * HALF);
#endif
#pragma unroll
            for (int m = 0; m < 4; ++m)
#pragma unroll
                for (int bj = 0; bj < 2; ++bj) { const size_t row = (size_t)(row0 + ai * HALF + m * 16); const int col = col0 + bj * HALF; float gl[8]; MH_UNPK(gg[m][bj], gl);
                    f32x4 v0 = acc[ai][bj][m][0], v1 = acc[ai][bj][m][1];
#pragma unroll
                    for (int j = 0; j < 4; ++j) { v0[j] *= sigmoidf_(gl[j]) * MGSC; v1[j] *= sigmoidf_(gl[4 + j]) * MGSC; }
                    unsigned w0 = 0, w1 = 0; w0 = __builtin_amdgcn_cvt_pk_fp8_f32(v0[0], v0[1], w0, false); w0 = __builtin_amdgcn_cvt_pk_fp8_f32(v0[2], v0[3], w0, true); w1 = __builtin_amdgcn_cvt_pk_fp8_f32(v1[0], v1[1], w1, false); w1 = __builtin_amdgcn_cvt_pk_fp8_f32(v1[2], v1[3], w1, true);
                    *(v2u*)((unsigned char*)msum + row * D + col) = (v2u){w0, w1}; }
            asm volatile("" ::: "memory"); }
    }
};
struct EpiResid {
    static constexpr bool PERM = true, AFTER_DRAIN = false; static constexpr int MID = 0;
    const void* X; bf16* Y; float sc; bool xbf;
    __device__ __forceinline__ void operator()(const f32x4 (&acc)[2][2][4][2], const Unit& u, int wr, int wc, int fr, int fq) const {
        const int row0 = u.pm * BM + wr * 64 + fr, col0 = u.pn * BM + wc * 32 + 8 * fq;
#pragma unroll
        for (int ai = 0; ai < 2; ++ai)
#pragma unroll
            for (int m = 0; m < 4; ++m) { const size_t off = (size_t)(row0 + ai * HALF + m * 16) * D + col0;
#pragma unroll
                for (int bj = 0; bj < 2; ++bj) { const f32x4 x0 = ld4(X, off + bj * HALF, xbf), x1 = ld4(X, off + bj * HALF + 4, xbf);
                    const f32x4 v0 = x0 * ALPHA + acc[ai][bj][m][0] * sc, v1 = x1 * ALPHA + acc[ai][bj][m][1] * sc;
                    u32x4 w; w.x = pk2(v0[0], v0[1]); w.y = pk2(v0[2], v0[3]); w.z = pk2(v1[0], v1[1]); w.w = pk2(v1[2], v1[3]); *(u32x4*)(Y + off + bj * HALF) = w; } }
    }
};
struct MoeTab {
    LAS int* t; LAS unsigned short* tok; LAS float* wt; LAS unsigned char* mte;
    __device__ __forceinline__ MoeTab(LAS unsigned char* lds) : t((LAS int*)(lds + TAB_OFF)), tok((LAS unsigned short*)(lds + TAB_OFF + 1024)), wt((LAS float*)(lds + TAB_OFF + 5120)), mte((LAS unsigned char*)(lds + TAB_OFF + 13312)) {}
};
__device__ __forceinline__ void moe_tables(const MoeTab& M, const unsigned* cnt  , int tid, int lane, int wave) {
    __syncthreads();
    if (wave == 0) { const int c = (int)cnt[64 * lane]; const int tiles = (c + 255) >> 8; const float incl = wave_scan_incl((float)tiles);
        M.t[80 + lane] = c; M.t[lane] = (int)incl - tiles; if (lane == 63) { M.t[64] = (int)incl; M.t[65] = (int)incl + T / 256; M.t[80 + 64] = T; } }
    __syncthreads();
    const int Mt = M.t[65];
    for (int mt = tid; mt < Mt; mt += 512) { int e = 0;
        for (int k = 1; k <= 64; ++k) e = (M.t[k] <= mt) ? k : e;
        M.mte[mt] = (unsigned char)e; }
    __syncthreads();
}
struct UpOrder {
    MoeTab M; int n;
    __device__ __forceinline__ bool next(int i, Unit& u) const { if (i >= n) return false; u.pm = M.t[168 + i]; u.pn = M.t[176 + i]; u.aux = i; return true; }
    __device__ __forceinline__ int row_token(int i, int r) const { return (int)M.tok[i * 256 + r]; }
    __device__ __forceinline__ void a_ready(const Unit&) const {}
    __device__ __forceinline__ void done(const Unit&) const {}
};
__device__ __forceinline__ int up_order_build(const MoeTab& M, const int* LIST, const float* WL, int wg, int G, int tid) {
    const int U = 4 * M.t[65];
    if (tid < 8) { const int L = tid * G + wg; if (L < U) { const int mt = L >> 2, q = L & 3, e = M.mte[mt]; M.t[168 + tid] = mt; M.t[176 + tid] = e * 4 + q; M.t[184 + tid] = e; M.t[192 + tid] = mt - M.t[e]; } }
    int n = 0;
#pragma unroll
    for (int i = 0; i < 8; ++i) n += (i * G + wg < U) ? 1 : 0;
    __syncthreads();
    for (int idx = tid; idx < n * 256; idx += 512) { const int i = idx >> 8, r = idx & 255, e = M.t[184 + i], li = M.t[192 + i] * 256 + r;
        int tk = 0; float w = 0.f;
        if (e < NE) { if (li < M.t[80 + e]) { tk = LIST[e * T + li]; w = WL[e * T + li]; } } else { tk = li; w = 1.f; }
        M.tok[idx] = (unsigned short)tk; M.wt[idx] = w; }
    __syncthreads();
    return n;
}
struct EpiGluSparse {
    static constexpr bool PERM = true, AFTER_DRAIN = false; static constexpr int MID = 0;
    LAS const float* wt; bf16* H;
    __device__ __forceinline__ void operator()(const f32x4 (&acc)[2][2][4][2], const Unit& u, int wr, int wc, int fr, int fq) const {
        const int q = u.pn & 3; const int rl0 = wr * 64 + fr, col0 = q * 128 + wc * 32 + 8 * fq;
#pragma unroll
        for (int ai = 0; ai < 2; ++ai)
#pragma unroll
            for (int m = 0; m < 4; ++m) { const int rl = rl0 + ai * HALF + m * 16; const float c = wt[u.aux * 256 + rl]; float h[8];
#pragma unroll
                for (int n = 0; n < 2; ++n)
#pragma unroll
                    for (int j = 0; j < 4; ++j) h[4 * n + j] = siluf_(acc[ai][0][m][n][j] * UPSC) * (acc[ai][1][m][n][j] * UPSC) * c;
#if MOE_DN_FP8
#pragma unroll
                for (int j = 0; j < 8; ++j) h[j] = __builtin_amdgcn_fmed3f(h[j] * HSC, -448.f, 448.f);
                unsigned w0 = 0, w1 = 0; w0 = __builtin_amdgcn_cvt_pk_fp8_f32(h[0], h[1], w0, false); w0 = __builtin_amdgcn_cvt_pk_fp8_f32(h[2], h[3], w0, true); w1 = __builtin_amdgcn_cvt_pk_fp8_f32(h[4], h[5], w1, false); w1 = __builtin_amdgcn_cvt_pk_fp8_f32(h[6], h[7], w1, true);
                *(v2u*)((unsigned char*)H + ((size_t)u.pm * 256 + rl) * ED + col0) = (v2u){w0, w1}; }
#else
                u32x4 w; w.x = pk2(h[0], h[1]); w.y = pk2(h[2], h[3]); w.z = pk2(h[4], h[5]); w.w = pk2(h[6], h[7]);
                *(u32x4*)(H + ((size_t)u.pm * 256 + rl) * ED + col0) = w; }
#endif
    }
};
struct DownOrder {
    MoeTab M; int G, c, U;
    __device__ __forceinline__ bool next(int i, Unit& u) const { const int L = i * G + c; if (L >= U) return false; const int mt = L >> 3, e = (int)M.mte[mt]; u.pm = mt; u.pn = e * 8 + (L & 7); const int left = M.t[80 + e] - 256 * (mt - M.t[e]); u.aux = left < 256 ? left : 256; return true; }
    __device__ __forceinline__ void a_ready(const Unit&) const {}
    __device__ __forceinline__ void done(const Unit&) const {}
};
struct EpiYexp {
    static constexpr bool PERM = true, AFTER_DRAIN = false; static constexpr int MID = 0;
    bf16* Y;
    __device__ __forceinline__ void operator()(const f32x4 (&acc)[2][2][4][2], const Unit& u, int wr, int wc, int fr, int fq) const {
        const int row0 = u.pm * BM + wr * 64 + fr, col0 = (u.pn & 7) * BM + wc * 32 + 8 * fq;
#pragma unroll
        for (int ai = 0; ai < 2; ++ai)
#pragma unroll
            for (int m = 0; m < 4; ++m) { bf16* rowp = Y + (size_t)(row0 + ai * HALF + m * 16) * D + col0;
                if (wr * 64 + fr + ai * HALF + m * 16 >= u.aux) continue;
#pragma unroll
                for (int bj = 0; bj < 2; ++bj) { const f32x4 v0 = acc[ai][bj][m][0] * DNSC, v1 = acc[ai][bj][m][1] * DNSC;
#if YEXP_FP8
                    *(v2u*)((unsigned char*)Y + (size_t)(row0 + ai * HALF + m * 16) * D + col0 + bj * HALF) = (v2u){pk4_f8(v0[0], v0[1], v0[2], v0[3], YSC), pk4_f8(v1[0], v1[1], v1[2], v1[3], YSC)}; } }
#else
                    u32x4 w; w.x = pk2(v0[0], v0[1]); w.y = pk2(v0[2], v0[3]); w.z = pk2(v1[0], v1[1]); w.w = pk2(v1[2], v1[3]); *(u32x4*)(rowp + bj * HALF) = w; } }
#endif
    }
};

struct TrItem { const float* src; bf16* dst; unsigned sld, dld; int f8; };
__device__ __forceinline__ void tr_load(const TrItem& t, int lane, v4f (&v)[8]) { const int r8 = lane >> 3, c4 = lane & 7;
#pragma unroll
    for (int i = 0; i < 8; ++i) v[i] = __builtin_nontemporal_load((const v4f*)(t.src + (size_t)(8 * i + r8) * t.sld + 4 * c4)); }
__device__ __forceinline__ void tr_store(const TrItem& t, const v4f (&v)[8], LAS float* scr, int lane, bool nostore = false) {
    { const int r8 = lane >> 3, c4 = lane & 7;
#pragma unroll
      for (int i = 0; i < 8; ++i) { LAS float* d = scr + (8 * i + r8) * 33 + 4 * c4; d[0] = v[i].x; d[1] = v[i].y; d[2] = v[i].z; d[3] = v[i].w; } }
    LDS_WAIT(); asm volatile("" ::: "memory");
    if (nostore) return;
    if (t.f8) {
        const int c = lane & 3;
#pragma unroll
        for (int j = 0; j < 2; ++j) { const int n = (lane >> 2) + 16 * j; const LAS float* s = scr + (16 * c) * 33 + n; unsigned w[4];
#pragma unroll
            for (int q = 0; q < 4; ++q) { unsigned x = 0; x = __builtin_amdgcn_cvt_pk_fp8_f32(s[(4 * q) * 33] * 64.f, s[(4 * q + 1) * 33] * 64.f, x, false); x = __builtin_amdgcn_cvt_pk_fp8_f32(s[(4 * q + 2) * 33] * 64.f, s[(4 * q + 3) * 33] * 64.f, x, true); w[q] = x; }
            __builtin_nontemporal_store((v4u){w[0], w[1], w[2], w[3]}, (v4u*)((unsigned char*)t.dst + (size_t)n * t.dld + 16 * c)); }
    } else {
        const int c = lane & 7;
#pragma unroll
        for (int j = 0; j < 4; ++j) { const int n = (lane >> 3) + 8 * j; const LAS float* s = scr + (8 * c) * 33 + n;
            v4u o; o.x = pk2(s[0 * 33], s[1 * 33]); o.y = pk2(s[2 * 33], s[3 * 33]); o.z = pk2(s[4 * 33], s[5 * 33]); o.w = pk2(s[6 * 33], s[7 * 33]);
            __builtin_nontemporal_store(o, (v4u*)(t.dst + (size_t)n * t.dld + 8 * c)); }
    }
    LDS_WAIT(); asm volatile("" ::: "memory");
}
template <int PART> __device__ __forceinline__ TrItem tr_decode(const Params& p, int l, int it) {
    unsigned char* ws = p.ws;
    constexpr int N_IN = (ZC / 32) * (D / 64), N_BR = 4 * (BW / 64) * (D / 32), N_OUT = (D / 64) * (D / 32), N_UP = NEX * 2 * (D / 64) * (ED / 32);
    int r = it; TrItem t; t.f8 = 0;
    if (PART == 0) {
        const float* w_in = p.in[I_WIN] + (size_t)l * D * INC; const float* w_br = p.in[I_WBR] + (size_t)l * 4 * BW * D; const float* w_out = p.in[I_WOUT] + (size_t)l * D * D;
        bf16* WIN = (bf16*)(ws + WS_WIN); bf16* WBR = (bf16*)(ws + WS_WBR); bf16* WOUT = (bf16*)(ws + WS_WOUT);
        if (r < N_IN) { const int kb = r / (ZC / 32), n0 = (r % (ZC / 32)) * 32, k0 = kb * 64; const int sc = n0 + (n0 >= ZC_GATE ? 16 : (n0 >= ZC_MLQ ? 8 : 0));
            t.src = w_in + (size_t)k0 * INC + sc; t.sld = INC; t.dst = (bf16*)((unsigned char*)WIN + (size_t)n0 * D + k0); t.dld = D; t.f8 = 1; return t; } r -= N_IN;
        if (r < N_BR) { const int g = r / 512, rr = r % 512, k0 = (rr / 64) * 64, n0 = (rr % 64) * 32;
            t.src = w_br + ((size_t)g * BW + k0) * D + n0; t.sld = D;
#if MERGE_FP8
            t.dst = (bf16*)((unsigned char*)WBR + (size_t)n0 * BRW + g * BW + k0); t.dld = BRW; t.f8 = 1; return t; }
#else
            t.dst = WBR + (size_t)n0 * BRW + g * BW + k0; t.dld = BRW; return t; }
#endif
        r -= N_BR;
        { const int k0 = (r / 64) * 64, n0 = (r % 64) * 32; t.src = w_out + (size_t)k0 * D + n0; t.sld = D; t.dst = (bf16*)((unsigned char*)WOUT + (size_t)n0 * D + k0); t.dld = D; t.f8 = 1; return t; }
    } else {
        const float* w_g = p.in[I_WG] + (size_t)l * NE * D * ED; const float* w_u = p.in[I_WU] + (size_t)l * NE * D * ED; const float* w_d = p.in[I_WD] + (size_t)l * NE * ED * D;
        const float* s_g = p.in[I_SG] + (size_t)l * D * ED; const float* s_u = p.in[I_SU] + (size_t)l * D * ED; const float* s_d = p.in[I_SD] + (size_t)l * ED * D;
        bf16* WUP = (bf16*)(ws + WS_WUP); bf16* WDN = (bf16*)(ws + WS_WDN);
        if (r < N_UP) { const int e = r / 1024, rr = r % 1024, mat = rr / 512, r2 = rr % 512, k0 = (r2 / 16) * 64, n0 = (r2 % 16) * 32;
            const float* sb = (e < NE) ? ((mat ? w_u : w_g) + (size_t)e * D * ED) : (mat ? s_u : s_g);
            const int drow = e * 1024 + (n0 / 128) * 256 + mat * 128 + (n0 % 128);
            t.src = sb + (size_t)k0 * ED + n0; t.sld = ED;
#if MOE_UP_FP8
            t.dst = (bf16*)((unsigned char*)WUP + (size_t)drow * D + k0); t.dld = D; t.f8 = 1; return t; }
#else
            t.dst = WUP + (size_t)drow * D + k0; t.dld = D; return t; }
#endif
        r -= N_UP;
        { const int e = r / 512, rr = r % 512, k0 = (rr / 64) * 64, n0 = (rr % 64) * 32;
            const float* sb = (e < NE) ? (w_d + (size_t)e * ED * D) : s_d;
            t.src = sb + (size_t)k0 * D + n0; t.sld = D;
#if MOE_DN_FP8
            t.dst = (bf16*)((unsigned char*)WDN + ((size_t)e * D + n0) * ED + k0); t.dld = ED; t.f8 = 1; return t; }
#else
            t.dst = WDN + ((size_t)e * D + n0) * ED + k0; t.dld = ED; return t; }
#endif
    }
}
template <int PART> __device__ __forceinline__ void phase_convert(const Params& p, int l, LAS unsigned char* lds, int gw, int NGW, int wave, int lane, bool nostore = false, int lo = 0, int hi = 1 << 30) {
    constexpr int N_IN = (ZC / 32) * (D / 64), N_BR = 4 * (BW / 64) * (D / 32), N_OUT = (D / 64) * (D / 32), N_UP = NEX * 2 * (D / 64) * (ED / 32), N_DN = NEX * (ED / 64) * (D / 32);
    constexpr int NITEMS = (PART == 0) ? (N_IN + N_BR + N_OUT) : (N_UP + N_DN);
    LAS float* scr = (LAS float*)(lds + wave * 16384);
    const int NIT = hi < NITEMS ? hi : NITEMS;
    if (lo + gw >= NIT) return;
    TrItem cur = tr_decode<PART>(p, l, lo + gw); v4f va[8], vb[8];
    tr_load(cur, lane, va);
    for (int it = lo + gw; it < NIT; it += 2 * NGW) {
        const int i1 = it + NGW, i2 = it + 2 * NGW; TrItem nx = cur;
        if (i1 < NIT) { nx = tr_decode<PART>(p, l, i1); } tr_load(nx, lane, vb);
        tr_store(cur, va, scr, lane, nostore);
        if (i1 >= NIT) break;
        cur = nx; if (i2 < NIT) { cur = tr_decode<PART>(p, l, i2); } tr_load(cur, lane, va);
        tr_store(nx, vb, scr, lane, nostore);
        if (i2 >= NIT) break;
    }
}
__device__ __forceinline__ void phase_xprep(const Params& p, int l, const void* xin, bool xbf, LAS unsigned char* lds, int gw, int NGW, int tid, int lane) {
    const float* w_in = p.in[I_WIN] + (size_t)l * D * INC;
    constexpr int XP = 2052; LAS float* xt = (LAS float*)lds; LAS float* part = (LAS float*)lds;
    const int wave = tid >> 6, n_l = lane & 15, kq = lane >> 4, wg = gw >> 3, G = NGW >> 3;
    const int colw = n_l < 8 ? 4608 + n_l : 6152 + (n_l - 8);
    float bw[64];
#pragma unroll
    for (int q = 0; q < 64; ++q) bw[q] = w_in[(size_t)(256 * wave + 16 * (q >> 2) + 4 * kq + (q & 3)) * INC + colw];
    unsigned char* XB = p.ws + WS_XB; float* SMALL = (float*)(p.ws + WS_SMALL);
    __syncthreads();
    for (int tg = wg; tg < T / 16; tg += G) {
        {   v4f va[8], vb[8]; const size_t m0 = (size_t)tg * 16 + 2 * wave;
#pragma unroll
            for (int j = 0; j < 8; ++j) { va[j] = ld4_nt(xin, m0 * D + 4 * lane + 256 * j, xbf); vb[j] = ld4_nt(xin, (m0 + 1) * D + 4 * lane + 256 * j, xbf); }
#pragma unroll
            for (int rr = 0; rr < 2; ++rr) { unsigned* xo = (unsigned*)(XB + (m0 + rr) * D) + lane;
#pragma unroll
                for (int j = 0; j < 8; ++j) { const v4f v = rr ? vb[j] : va[j]; unsigned w = 0; w = __builtin_amdgcn_cvt_pk_fp8_f32(v.x, v.y, w, false); w = __builtin_amdgcn_cvt_pk_fp8_f32(v.z, v.w, w, true); xo[64 * j] = w;
                    *(LAS v4f*)(xt + (2 * wave + rr) * XP + 4 * lane + 256 * j) = v; } } }
        __syncthreads();
        {   pg8::f32x4 acc[4];
#pragma unroll
            for (int i = 0; i < 4; ++i) acc[i] = (pg8::f32x4){0.f, 0.f, 0.f, 0.f};
            const LAS float* xa = xt + n_l * XP + 256 * wave + 4 * kq;
#pragma unroll
            for (int s2 = 0; s2 < 16; ++s2) { const v4f a4 = *(const LAS v4f*)(xa + 16 * s2);
                acc[0] = __builtin_amdgcn_mfma_f32_16x16x4f32(a4.x, bw[4 * s2 + 0], acc[0], 0, 0, 0); acc[1] = __builtin_amdgcn_mfma_f32_16x16x4f32(a4.y, bw[4 * s2 + 1], acc[1], 0, 0, 0);
                acc[2] = __builtin_amdgcn_mfma_f32_16x16x4f32(a4.z, bw[4 * s2 + 2], acc[2], 0, 0, 0); acc[3] = __builtin_amdgcn_mfma_f32_16x16x4f32(a4.w, bw[4 * s2 + 3], acc[3], 0, 0, 0); }
            const pg8::f32x4 tot = (acc[0] + acc[1]) + (acc[2] + acc[3]);
            __syncthreads();
#pragma unroll
            for (int j = 0; j < 4; ++j) part[(wave * 16 + 4 * kq + j) * 16 + n_l] = tot[j]; }
        __syncthreads();
        if (tid < 256) { float a = 0.f;
#pragma unroll
            for (int w = 0; w < 8; ++w) a += part[w * 256 + tid];
            SMALL[(size_t)tg * 256 + tid] = a; }
        __syncthreads();
    }
}


typedef short bf16x8_t __attribute__((ext_vector_type(8)));
__device__ __forceinline__ void ml_pre_item(const Params& p, int l, LAS unsigned char* lds, int item, int tid, int wave, int lane) {
    const int h = item & 3, n = item >> 2; const size_t t0 = (size_t)n * 64;
    const bf16* Z = (const bf16*)(p.ws + WS_Z); const float* SMALL = (const float*)(p.ws + WS_SMALL);
    bf16* MQ = (bf16*)(p.ws + WS_MQ) + (size_t)item * 4096; bf16* MS = (bf16*)(p.ws + WS_MS) + (size_t)item * 4096; bf16* MK = (bf16*)(p.ws + WS_MK) + (size_t)item * 4096;
    bf16* MV = (bf16*)(p.ws + WS_MV) + (size_t)item * 9216; float* MFL = (float*)(p.ws + WS_MFL);
    LAS float* qs = (LAS float*)lds;
    LAS float* ks = qs + 64 * 65;
    LAS float* bs = ks + 64 * 65;
    LAS unsigned short* vs = (LAS unsigned short*)(bs + 128);
    { const int tk = tid >> 3, c8 = tid & 7; float f[8];
      unpack8(*(const v4u*)(Z + (t0 + tk) * ZC + ZC_MLQ + h * 64 + 8 * c8), f);
#pragma unroll
      for (int i = 0; i < 8; ++i) qs[tk * 65 + 8 * c8 + i] = f[i];
      unpack8(*(const v4u*)(Z + (t0 + tk) * ZC + ZC_MLK + h * 64 + 8 * c8), f);
#pragma unroll
      for (int i = 0; i < 8; ++i) ks[tk * 65 + 8 * c8 + i] = f[i]; }
#pragma unroll
    for (int r = 0; r < 2; ++r) { const int idx = tid + 512 * r, tk = idx >> 4, c8 = idx & 15;
        *(LAS v4u*)(vs + tk * 136 + 8 * c8) = *(const v4u*)(Z + (t0 + tk) * ZC + ZC_MLV + h * 128 + 8 * c8); }
    if (wave == 0) { const float fp = SMALL[(t0 + lane) * 16 + 12 + h] + p.in[I_MLFB][l * 4 + h]; const float lf = -softplusf_(-fp);
        bs[lane] = wave_scan_incl(lf); bs[64 + lane] = SMALL[(t0 + lane) * 16 + 8 + h] + p.in[I_MLIB][l * 4 + h]; }
    __syncthreads();
    const float blast = bs[63];
    { const int i = tid >> 3, jb = tid & 7; const float bi = bs[i];
      { const float e = __expf(bi) * 0.125f; float o[8];
#pragma unroll
        for (int x = 0; x < 8; ++x) o[x] = qs[i * 65 + 8 * jb + x] * e;
        v4u w; w.x = pk2(o[0], o[1]); w.y = pk2(o[2], o[3]); w.z = pk2(o[4], o[5]); w.w = pk2(o[6], o[7]); *(v4u*)(MQ + i * 64 + 8 * jb) = w; }
      {
          const int ti = wave >> 1, c16 = lane & 15, g4 = lane >> 4, i2 = 16 * ti + c16; const float bi2 = bs[i2];
#define ML_F8(dst, base) do { const LAS float* _b = (base); const v4u _w = (v4u){pg8::cvt_pk_bf16(_b[0], _b[1]), pg8::cvt_pk_bf16(_b[2], _b[3]), pg8::cvt_pk_bf16(_b[4], _b[5]), pg8::cvt_pk_bf16(_b[6], _b[7])}; dst = __builtin_bit_cast(bf16x8_t, _w); } while (0)
          bf16x8_t bq[2];
#pragma unroll
          for (int s2 = 0; s2 < 2; ++s2) ML_F8(bq[s2], qs + i2 * 65 + 32 * s2 + 8 * g4);
#pragma unroll
          for (int jj = 0; jj < 2; ++jj) { const int tj = 2 * (wave & 1) + jj; v2u sw = (v2u){0u, 0u};
              if (tj <= ti) { pg8::f32x4 d = {0.f, 0.f, 0.f, 0.f};
#pragma unroll
                  for (int s2 = 0; s2 < 2; ++s2) { bf16x8_t a; ML_F8(a, ks + (16 * tj + c16) * 65 + 32 * s2 + 8 * g4); d = __builtin_amdgcn_mfma_f32_16x16x32_bf16(a, bq[s2], d, 0, 0, 0); }
                  float v4[4];
#pragma unroll
                  for (int r = 0; r < 4; ++r) { const int j = 16 * tj + 4 * g4 + r; v4[r] = (j <= i2) ? __expf(bi2 - bs[j] + bs[64 + j]) * d[r] * 0.125f : 0.f; }
                  sw = (v2u){pk2(v4[0], v4[1]), pk2(v4[2], v4[3])}; }
              *(v2u*)(MS + i2 * 64 + 16 * tj + 4 * g4) = sw; }
#undef ML_F8
      }
      { float o[8];
#pragma unroll
        for (int x = 0; x < 8; ++x) { const int j = 8 * jb + x; o[x] = ks[j * 65 + i] * __expf(blast - bs[j] + bs[64 + j]); }
        v4u w; w.x = pk2(o[0], o[1]); w.y = pk2(o[2], o[3]); w.z = pk2(o[4], o[5]); w.w = pk2(o[6], o[7]); *(v4u*)(MK + i * 64 + 8 * jb) = w; }
    }
    { const int c = tid >> 2, jq = tid & 3; unsigned w[8];
#pragma unroll
      for (int x = 0; x < 8; ++x) w[x] = (unsigned)vs[(16 * jq + 2 * x) * 136 + c] | ((unsigned)vs[(16 * jq + 2 * x + 1) * 136 + c] << 16);
      *(v4u*)(MV + c * 64 + 16 * jq) = (v4u){w[0], w[1], w[2], w[3]}; *(v4u*)(MV + c * 64 + 16 * jq + 8) = (v4u){w[4], w[5], w[6], w[7]};
      if (tid < 64) { const int c2 = 128 + (tid >> 2); const unsigned one = (c2 == 128) ? 0x3F803F80u : 0u;
          *(v4u*)(MV + c2 * 64 + 16 * jq) = (v4u){one, one, one, one}; *(v4u*)(MV + c2 * 64 + 16 * jq + 8) = (v4u){one, one, one, one}; } }
    if (tid == 0) MFL[item] = __expf(blast);
    __syncthreads();
}
struct MlFrags { bf16x8_t q[2], s[2], kt[2], vt[2]; float fl; };
__device__ __forceinline__ void ml_load(MlFrags& F, const Params& p, int item, int offA, int offV) {
    const bf16* MQ = (const bf16*)(p.ws + WS_MQ) + (size_t)item * 4096; const bf16* MS = (const bf16*)(p.ws + WS_MS) + (size_t)item * 4096; const bf16* MK = (const bf16*)(p.ws + WS_MK) + (size_t)item * 4096;
    const bf16* MV = (const bf16*)(p.ws + WS_MV) + (size_t)item * 9216;
#pragma unroll
    for (int ks = 0; ks < 2; ++ks) { F.q[ks] = *(const bf16x8_t*)(MQ + offA + 32 * ks); F.s[ks] = *(const bf16x8_t*)(MS + offA + 32 * ks); F.kt[ks] = *(const bf16x8_t*)(MK + offA + 32 * ks); F.vt[ks] = *(const bf16x8_t*)(MV + offV + 32 * ks); }
    F.fl = ((const float*)(p.ws + WS_MFL))[item];
}
__device__ __forceinline__ void ml_seq(const Params& p, LAS unsigned char* lds, int wgi, int wave, int lane) {
    const int u = wgi * 2 + (wave >> 2), wi = wave & 3, h = u / 9, sl = u % 9, g = lane >> 4, c = lane & 15;
    LAS unsigned short* CT = (LAS unsigned short*)(lds + (wave >> 2) * 4096);
    float* HO = (float*)(p.ws + WS_HO); float* HDEN = (float*)(p.ws + WS_HDEN);
    const int offA = (16 * wi + c) * 64 + 8 * g, offV = (16 * sl + c) * 64 + 8 * g;
    *(LAS v2u*)(CT + c * 64 + 16 * wi + 4 * g) = (v2u){0u, 0u};
    pg8::f32x4 Cacc = {0.f, 0.f, 0.f, 0.f};
    __syncthreads();
    MlFrags F0, F1;
    ml_load(F0, p, h, offA, offV);
#define ML_STEP(F, n_) do { const int cur = (n_) & 1; \
        const bf16x8_t c0 = *(const LAS bf16x8_t*)(CT + cur * 1024 + c * 64 + 8 * g), c1 = *(const LAS bf16x8_t*)(CT + cur * 1024 + c * 64 + 32 + 8 * g); \
        pg8::f32x4 num = {0.f, 0.f, 0.f, 0.f}; \
        num = __builtin_amdgcn_mfma_f32_16x16x32_bf16(F.q[0], c0, num, 0, 0, 0); num = __builtin_amdgcn_mfma_f32_16x16x32_bf16(F.q[1], c1, num, 0, 0, 0); \
        num = __builtin_amdgcn_mfma_f32_16x16x32_bf16(F.s[0], F.vt[0], num, 0, 0, 0); num = __builtin_amdgcn_mfma_f32_16x16x32_bf16(F.s[1], F.vt[1], num, 0, 0, 0); \
        Cacc = Cacc * F.fl; \
        Cacc = __builtin_amdgcn_mfma_f32_16x16x32_bf16(F.kt[0], F.vt[0], Cacc, 0, 0, 0); Cacc = __builtin_amdgcn_mfma_f32_16x16x32_bf16(F.kt[1], F.vt[1], Cacc, 0, 0, 0); \
        { v2u w; w.x = pk2(Cacc[0], Cacc[1]); w.y = pk2(Cacc[2], Cacc[3]); *(LAS v2u*)(CT + (cur ^ 1) * 1024 + c * 64 + 16 * wi + 4 * g) = w; } \
        { const size_t tb = (size_t)(n_) * 64 + 16 * wi + 4 * g; \
          if (sl < 8) { _Pragma("unroll") for (int r = 0; r < 4; ++r) HO[(tb + r) * BW + h * 128 + 16 * sl + c] = num[r]; } \
          else if (c == 0) { _Pragma("unroll") for (int r = 0; r < 4; ++r) HDEN[(tb + r) * 4 + h] = num[r]; } } \
        LDS_BAR(); } while (0)
    for (int n = 0; n < T / 64; n += 2) {
        ml_load(F1, p, (n + 1) * 4 + h, offA, offV);
        ML_STEP(F0, n);
        ml_load(F0, p, ((n + 2 < T / 64) ? n + 2 : n) * 4 + h, offA, offV);
        ML_STEP(F1, n + 1);
    }
#undef ML_STEP
}


constexpr int QP = 132;
__device__ __forceinline__ void gdn_pre_item(const Params& p, int l, LAS unsigned char* lds, int item, int tid, int wave, int lane) {
    const int h = item & 3, n = item >> 2; const size_t t0 = (size_t)n * 64;
    const bf16* Z = (const bf16*)(p.ws + WS_Z); const float* SMALL = (const float*)(p.ws + WS_SMALL);
    float* GU = (float*)(p.ws + WS_GU) + (size_t)item * 8192; bf16* GNW = (bf16*)(p.ws + WS_GNW) + (size_t)item * 8192; bf16* GQG = (bf16*)(p.ws + WS_GQG) + (size_t)item * 8192;
    bf16* GAT = (bf16*)(p.ws + WS_GAT) + (size_t)item * 4096; bf16* GKT = (bf16*)(p.ws + WS_GKT) + (size_t)item * 8192; float* GDL = (float*)(p.ws + WS_GDL);
    const float* cw = p.in[I_CONVW] + (size_t)l * 4 * 1536;
    LAS float* qs = (LAS float*)lds; LAS float* ks = qs + 64 * QP; LAS float* vs = ks + 64 * QP; LAS float* Ls = vs + 64 * QP;   LAS float* gcs = Ls + 64 * 68; LAS float* bts = gcs + 64; LAS float* btg = bts + 64;
    LAS unsigned short* zq = (LAS unsigned short*)(lds + 131584); LAS unsigned short* zk = (LAS unsigned short*)Ls; LAS unsigned short* zv = (LAS unsigned short*)vs; LAS float* cwl = btg + 64;
    float gate_b = 0.f, gate_a = 0.f; if (wave == 0) { gate_b = SMALL[(t0 + lane) * 16 + h]; gate_a = SMALL[(t0 + lane) * 16 + 4 + h]; }
    {   v4u zr[7]; v4f wr4 = (v4f){0.f, 0.f, 0.f, 0.f};
#pragma unroll
        for (int q = 0; q < 7; ++q) { const int idx = tid + 512 * q; zr[q] = (v4u){0u, 0u, 0u, 0u};
            if (idx < 3216) { const int seg = idx / 1072, rem = idx % 1072, r = rem >> 4, c16 = rem & 15; const long tt = (long)t0 - 3 + r;
                if (tt >= 0) zr[q] = *(const v4u*)(Z + (size_t)tt * ZC + ZC_GDN + seg * 512 + h * 128 + 8 * c16); } }
        if (tid < 384) { const int j = tid / 96, rest = tid % 96, i = rest >> 5, c4 = rest & 31; wr4 = *(const v4f*)(cw + j * 1536 + i * 512 + h * 128 + 4 * c4); }
#pragma unroll
        for (int q = 0; q < 7; ++q) { const int idx = tid + 512 * q;
            if (idx < 3216) { const int seg = idx / 1072, rem = idx % 1072; LAS unsigned short* zb = seg == 0 ? zq : (seg == 1 ? zk : zv); *(LAS v4u*)(zb + 8 * rem) = zr[q]; } }
        if (tid < 384) *(LAS v4f*)(cwl + 4 * tid) = wr4;
    }
    __syncthreads();
    { const int tk = tid >> 3, part = tid & 7; float av[16];
#pragma unroll 1
      for (int i = 0; i < 3; ++i) { float a[16]; const LAS unsigned short* zb = i == 0 ? zq : (i == 1 ? zk : zv);
#pragma unroll
        for (int x = 0; x < 16; ++x) a[x] = 0.f;
#pragma unroll
        for (int j = 0; j < 4; ++j) { const LAS unsigned short* src = zb + (tk + j) * 128 + 16 * part; float x0[8], x1[8]; unpack8(*(const LAS v4u*)src, x0); unpack8(*(const LAS v4u*)(src + 8), x1);
            const LAS float* wp = cwl + (j * 3 + i) * 128 + 16 * part;
#pragma unroll
            for (int x4 = 0; x4 < 2; ++x4) { const v4f w0 = *(const LAS v4f*)(wp + 4 * x4), w1 = *(const LAS v4f*)(wp + 8 + 4 * x4);
                a[4 * x4] += w0.x * x0[4 * x4]; a[4 * x4 + 1] += w0.y * x0[4 * x4 + 1]; a[4 * x4 + 2] += w0.z * x0[4 * x4 + 2]; a[4 * x4 + 3] += w0.w * x0[4 * x4 + 3];
                a[8 + 4 * x4] += w1.x * x1[4 * x4]; a[8 + 4 * x4 + 1] += w1.y * x1[4 * x4 + 1]; a[8 + 4 * x4 + 2] += w1.z * x1[4 * x4 + 2]; a[8 + 4 * x4 + 3] += w1.w * x1[4 * x4 + 3]; } }
        float ss = 0.f;
#pragma unroll
        for (int x = 0; x < 16; ++x) { a[x] = siluf_(a[x]); ss += a[x] * a[x]; }
        if (i < 2) { ss = sum8(ss); const float r = rsqrtf(ss + 1e-6f) * (i == 0 ? 0.08838834764831845f : 1.f);
#pragma unroll
            for (int x = 0; x < 16; ++x) a[x] *= r;
            LAS float* dst = (i == 0 ? qs : ks) + tk * QP + 16 * part;
#pragma unroll
            for (int x4 = 0; x4 < 4; ++x4) *(LAS v4f*)(dst + 4 * x4) = (v4f){a[4 * x4], a[4 * x4 + 1], a[4 * x4 + 2], a[4 * x4 + 3]}; }
        else {
#pragma unroll
            for (int x = 0; x < 16; ++x) av[x] = a[x]; } }
      __syncthreads();
      { LAS float* dst = vs + tk * QP + 16 * part;
#pragma unroll
        for (int x4 = 0; x4 < 4; ++x4) *(LAS v4f*)(dst + 4 * x4) = (v4f){av[4 * x4], av[4 * x4 + 1], av[4 * x4 + 2], av[4 * x4 + 3]}; } }
    if (wave == 0) { const float bb = gate_b, aa = gate_a;
        const float g = -__expf(p.in[I_ALOG][l * 4 + h]) * softplusf_(aa + p.in[I_DTB][l * 4 + h]);
        const float gc = wave_scan_incl(g), bt = sigmoidf_(bb); gcs[lane] = gc; bts[lane] = bt; btg[lane] = bt * __expf(gc); }
    __syncthreads();
    { const int ti = wave >> 1, c16 = lane & 15, g4 = lane >> 4, i = 16 * ti + c16; const float gi = gcs[i], bi = bts[i];
#define GDN_F8(dst, base) do { const v4f _a = *(const LAS v4f*)(base), _b = *(const LAS v4f*)((base) + 4); const v4u _w = (v4u){pg8::cvt_pk_bf16(_a.x, _a.y), pg8::cvt_pk_bf16(_a.z, _a.w), pg8::cvt_pk_bf16(_b.x, _b.y), pg8::cvt_pk_bf16(_b.z, _b.w)}; dst = __builtin_bit_cast(bf16x8_t, _w); } while (0)
      bf16x8_t bk[4], bq[4];
#pragma unroll
      for (int s4 = 0; s4 < 4; ++s4) { GDN_F8(bk[s4], ks + i * QP + 32 * s4 + 8 * g4); GDN_F8(bq[s4], qs + i * QP + 32 * s4 + 8 * g4); }
#pragma unroll
      for (int jj = 0; jj < 2; ++jj) { const int tj = 2 * (wave & 1) + jj; v4f lv = (v4f){0.f, 0.f, 0.f, 0.f}; v2u aw = (v2u){0u, 0u};
          if (tj <= ti) { pg8::f32x4 dk = {0.f, 0.f, 0.f, 0.f}, dq = {0.f, 0.f, 0.f, 0.f};
#pragma unroll
              for (int s4 = 0; s4 < 4; ++s4) { bf16x8_t a; GDN_F8(a, ks + (16 * tj + c16) * QP + 32 * s4 + 8 * g4);
                  dk = __builtin_amdgcn_mfma_f32_16x16x32_bf16(a, bk[s4], dk, 0, 0, 0); dq = __builtin_amdgcn_mfma_f32_16x16x32_bf16(a, bq[s4], dq, 0, 0, 0); }
              float l4[4], a4[4];
#pragma unroll
              for (int r = 0; r < 4; ++r) { const int j = 16 * tj + 4 * g4 + r; const float dc = __expf(gi - gcs[j]); l4[r] = (j < i) ? bi * dk[r] * dc : 0.f; a4[r] = (j <= i) ? dq[r] * dc : 0.f; }
              lv = (v4f){l4[0], l4[1], l4[2], l4[3]}; aw = (v2u){pk2(a4[0], a4[1]), pk2(a4[2], a4[3])}; }
          *(LAS v4f*)(Ls + i * 68 + 16 * tj + 4 * g4) = lv; *(v2u*)(GAT + i * 64 + 16 * tj + 4 * g4) = aw; }
#undef GDN_F8
    }
    __syncthreads();
    if (tid < 256) {
        const int c = tid; int vz; asm volatile("v_mov_b32 %0, 0" : "=v"(vz));
        const LAS float* rp = (c < 128) ? (vs + c) : (ks + (c - 128)); const LAS float* mp = ((c < 128) ? bts : btg) + vz;
#define GDN_RHS(i) (rp[(i) * QP] * mp[(i)])
#define GDN_L4(i, j4) (*(const LAS v4f*)(Ls + (i) * 68 + 4 * (j4) + vz))
        float x0 = GDN_RHS(0); __builtin_amdgcn_sched_barrier(0);
        float x1 = GDN_RHS(1); { const v4f l0 = GDN_L4(1, 0); __builtin_amdgcn_sched_barrier(0); x1 -= l0.x * x0; } __builtin_amdgcn_sched_barrier(0);
        float x2 = GDN_RHS(2); { const v4f l0 = GDN_L4(2, 0); __builtin_amdgcn_sched_barrier(0); x2 -= l0.x * x0; x2 -= l0.y * x1; } __builtin_amdgcn_sched_barrier(0);
        float x3 = GDN_RHS(3); { const v4f l0 = GDN_L4(3, 0); __builtin_amdgcn_sched_barrier(0); x3 -= l0.x * x0; x3 -= l0.y * x1; x3 -= l0.z * x2; } __builtin_amdgcn_sched_barrier(0);
        float x4 = GDN_RHS(4); { const v4f l0 = GDN_L4(4, 0); __builtin_amdgcn_sched_barrier(0); x4 -= l0.x * x0; x4 -= l0.y * x1; x4 -= l0.z * x2; x4 -= l0.w * x3; } __builtin_amdgcn_sched_barrier(0);
        float x5 = GDN_RHS(5); { const v4f l0 = GDN_L4(5, 0); const v4f l1 = GDN_L4(5, 1); __builtin_amdgcn_sched_barrier(0); x5 -= l0.x * x0; x5 -= l0.y * x1; x5 -= l0.z * x2; x5 -= l0.w * x3; x5 -= l1.x * x4; } __builtin_amdgcn_sched_barrier(0);
        float x6 = GDN_RHS(6); { const v4f l0 = GDN_L4(6, 0); const v4f l1 = GDN_L4(6, 1); __builtin_amdgcn_sched_barrier(0); x6 -= l0.x * x0; x6 -= l0.y * x1; x6 -= l0.z * x2; x6 -= l0.w * x3; x6 -= l1.x * x4; x6 -= l1.y * x5; } __builtin_amdgcn_sched_barrier(0);
        float x7 = GDN_RHS(7); { const v4f l0 = GDN_L4(7, 0); const v4f l1 = GDN_L4(7, 1); __builtin_amdgcn_sched_barrier(0); x7 -= l0.x * x0; x7 -= l0.y * x1; x7 -= l0.z * x2; x7 -= l0.w * x3; x7 -= l1.x * x4; x7 -= l1.y * x5; x7 -= l1.z * x6; } __builtin_amdgcn_sched_barrier(0);
        float x8 = GDN_RHS(8); { const v4f l0 = GDN_L4(8, 0); const v4f l1 = GDN_L4(8, 1); __builtin_amdgcn_sched_barrier(0); x8 -= l0.x * x0; x8 -= l0.y * x1; x8 -= l0.z * x2; x8 -= l0.w * x3; x8 -= l1.x * x4; x8 -= l1.y * x5; x8 -= l1.z * x6; x8 -= l1.w * x7; } __builtin_amdgcn_sched_barrier(0);
        float x9 = GDN_RHS(9); { const v4f l0 = GDN_L4(9, 0); const v4f l1 = GDN_L4(9, 1); const v4f l2 = GDN_L4(9, 2); __builtin_amdgcn_sched_barrier(0); x9 -= l0.x * x0; x9 -= l0.y * x1; x9 -= l0.z * x2; x9 -= l0.w * x3; x9 -= l1.x * x4; x9 -= l1.y * x5; x9 -= l1.z * x6; x9 -= l1.w * x7; x9 -= l2.x * x8; } __builtin_amdgcn_sched_barrier(0);
        float x10 = GDN_RHS(10); { const v4f l0 = GDN_L4(10, 0); const v4f l1 = GDN_L4(10, 1); const v4f l2 = GDN_L4(10, 2); __builtin_amdgcn_sched_barrier(0); x10 -= l0.x * x0; x10 -= l0.y * x1; x10 -= l0.z * x2; x10 -= l0.w * x3; x10 -= l1.x * x4; x10 -= l1.y * x5; x10 -= l1.z * x6; x10 -= l1.w * x7; x10 -= l2.x * x8; x10 -= l2.y * x9; } __builtin_amdgcn_sched_barrier(0);
        float x11 = GDN_RHS(11); { const v4f l0 = GDN_L4(11, 0); const v4f l1 = GDN_L4(11, 1); const v4f l2 = GDN_L4(11, 2); __builtin_amdgcn_sched_barrier(0); x11 -= l0.x * x0; x11 -= l0.y * x1; x11 -= l0.z * x2; x11 -= l0.w * x3; x11 -= l1.x * x4; x11 -= l1.y * x5; x11 -= l1.z * x6; x11 -= l1.w * x7; x11 -= l2.x * x8; x11 -= l2.y * x9; x11 -= l2.z * x10; } __builtin_amdgcn_sched_barrier(0);
        float x12 = GDN_RHS(12); { const v4f l0 = GDN_L4(12, 0); const v4f l1 = GDN_L4(12, 1); const v4f l2 = GDN_L4(12, 2); __builtin_amdgcn_sched_barrier(0); x12 -= l0.x * x0; x12 -= l0.y * x1; x12 -= l0.z * x2; x12 -= l0.w * x3; x12 -= l1.x * x4; x12 -= l1.y * x5; x12 -= l1.z * x6; x12 -= l1.w * x7; x12 -= l2.x * x8; x12 -= l2.y * x9; x12 -= l2.z * x10; x12 -= l2.w * x11; } __builtin_amdgcn_sched_barrier(0);
        float x13 = GDN_RHS(13); { const v4f l0 = GDN_L4(13, 0); const v4f l1 = GDN_L4(13, 1); const v4f l2 = GDN_L4(13, 2); const v4f l3 = GDN_L4(13, 3); __builtin_amdgcn_sched_barrier(0); x13 -= l0.x * x0; x13 -= l0.y * x1; x13 -= l0.z * x2; x13 -= l0.w * x3; x13 -= l1.x * x4; x13 -= l1.y * x5; x13 -= l1.z * x6; x13 -= l1.w * x7; x13 -= l2.x * x8; x13 -= l2.y * x9; x13 -= l2.z * x10; x13 -= l2.w * x11; x13 -= l3.x * x12; } __builtin_amdgcn_sched_barrier(0);
        float x14 = GDN_RHS(14); { const v4f l0 = GDN_L4(14, 0); const v4f l1 = GDN_L4(14, 1); const v4f l2 = GDN_L4(14, 2); const v4f l3 = GDN_L4(14, 3); __builtin_amdgcn_sched_barrier(0); x14 -= l0.x * x0; x14 -= l0.y * x1; x14 -= l0.z * x2; x14 -= l0.w * x3; x14 -= l1.x * x4; x14 -= l1.y * x5; x14 -= l1.z * x6; x14 -= l1.w * x7; x14 -= l2.x * x8; x14 -= l2.y * x9; x14 -= l2.z * x10; x14 -= l2.w * x11; x14 -= l3.x * x12; x14 -= l3.y * x13; } __builtin_amdgcn_sched_barrier(0);
        float x15 = GDN_RHS(15); { const v4f l0 = GDN_L4(15, 0); const v4f l1 = GDN_L4(15, 1); const v4f l2 = GDN_L4(15, 2); const v4f l3 = GDN_L4(15, 3); __builtin_amdgcn_sched_barrier(0); x15 -= l0.x * x0; x15 -= l0.y * x1; x15 -= l0.z * x2; x15 -= l0.w * x3; x15 -= l1.x * x4; x15 -= l1.y * x5; x15 -= l1.z * x6; x15 -= l1.w * x7; x15 -= l2.x * x8; x15 -= l2.y * x9; x15 -= l2.z * x10; x15 -= l2.w * x11; x15 -= l3.x * x12; x15 -= l3.y * x13; x15 -= l3.z * x14; } __builtin_amdgcn_sched_barrier(0);
        float x16 = GDN_RHS(16); { const v4f l0 = GDN_L4(16, 0); const v4f l1 = GDN_L4(16, 1); const v4f l2 = GDN_L4(16, 2); const v4f l3 = GDN_L4(16, 3); __builtin_amdgcn_sched_barrier(0); x16 -= l0.x * x0; x16 -= l0.y * x1; x16 -= l0.z * x2; x16 -= l0.w * x3; x16 -= l1.x * x4; x16 -= l1.y * x5; x16 -= l1.z * x6; x16 -= l1.w * x7; x16 -= l2.x * x8; x16 -= l2.y * x9; x16 -= l2.z * x10; x16 -= l2.w * x11; x16 -= l3.x * x12; x16 -= l3.y * x13; x16 -= l3.z * x14; x16 -= l3.w * x15; } __builtin_amdgcn_sched_barrier(0);
        float x17 = GDN_RHS(17); { const v4f l0 = GDN_L4(17, 0); const v4f l1 = GDN_L4(17, 1); const v4f l2 = GDN_L4(17, 2); const v4f l3 = GDN_L4(17, 3); const v4f l4 = GDN_L4(17, 4); __builtin_amdgcn_sched_barrier(0); x17 -= l0.x * x0; x17 -= l0.y * x1; x17 -= l0.z * x2; x17 -= l0.w * x3; x17 -= l1.x * x4; x17 -= l1.y * x5; x17 -= l1.z * x6; x17 -= l1.w * x7; x17 -= l2.x * x8; x17 -= l2.y * x9; x17 -= l2.z * x10; x17 -= l2.w * x11; x17 -= l3.x * x12; x17 -= l3.y * x13; x17 -= l3.z * x14; x17 -= l3.w * x15; x17 -= l4.x * x16; } __builtin_amdgcn_sched_barrier(0);
        float x18 = GDN_RHS(18); { const v4f l0 = GDN_L4(18, 0); const v4f l1 = GDN_L4(18, 1); const v4f l2 = GDN_L4(18, 2); const v4f l3 = GDN_L4(18, 3); const v4f l4 = GDN_L4(18, 4); __builtin_amdgcn_sched_barrier(0); x18 -= l0.x * x0; x18 -= l0.y * x1; x18 -= l0.z * x2; x18 -= l0.w * x3; x18 -= l1.x * x4; x18 -= l1.y * x5; x18 -= l1.z * x6; x18 -= l1.w * x7; x18 -= l2.x * x8; x18 -= l2.y * x9; x18 -= l2.z * x10; x18 -= l2.w * x11; x18 -= l3.x * x12; x18 -= l3.y * x13; x18 -= l3.z * x14; x18 -= l3.w * x15; x18 -= l4.x * x16; x18 -= l4.y * x17; } __builtin_amdgcn_sched_barrier(0);
        float x19 = GDN_RHS(19); { const v4f l0 = GDN_L4(19, 0); const v4f l1 = GDN_L4(19, 1); const v4f l2 = GDN_L4(19, 2); const v4f l3 = GDN_L4(19, 3); const v4f l4 = GDN_L4(19, 4); __builtin_amdgcn_sched_barrier(0); x19 -= l0.x * x0; x19 -= l0.y * x1; x19 -= l0.z * x2; x19 -= l0.w * x3; x19 -= l1.x * x4; x19 -= l1.y * x5; x19 -= l1.z * x6; x19 -= l1.w * x7; x19 -= l2.x * x8; x19 -= l2.y * x9; x19 -= l2.z * x10; x19 -= l2.w * x11; x19 -= l3.x * x12; x19 -= l3.y * x13; x19 -= l3.z * x14; x19 -= l3.w * x15; x19 -= l4.x * x16; x19 -= l4.y * x17; x19 -= l4.z * x18; } __builtin_amdgcn_sched_barrier(0);
        float x20 = GDN_RHS(20); { const v4f l0 = GDN_L4(20, 0); const v4f l1 = GDN_L4(20, 1); const v4f l2 = GDN_L4(20, 2); const v4f l3 = GDN_L4(20, 3); const v4f l4 = GDN_L4(20, 4); __builtin_amdgcn_sched_barrier(0); x20 -= l0.x * x0; x20 -= l0.y * x1; x20 -= l0.z * x2; x20 -= l0.w * x3; x20 -= l1.x * x4; x20 -= l1.y * x5; x20 -= l1.z * x6; x20 -= l1.w * x7; x20 -= l2.x * x8; x20 -= l2.y * x9; x20 -= l2.z * x10; x20 -= l2.w * x11; x20 -= l3.x * x12; x20 -= l3.y * x13; x20 -= l3.z * x14; x20 -= l3.w * x15; x20 -= l4.x * x16; x20 -= l4.y * x17; x20 -= l4.z * x18; x20 -= l4.w * x19; } __builtin_amdgcn_sched_barrier(0);
        float x21 = GDN_RHS(21); { const v4f l0 = GDN_L4(21, 0); const v4f l1 = GDN_L4(21, 1); const v4f l2 = GDN_L4(21, 2); const v4f l3 = GDN_L4(21, 3); const v4f l4 = GDN_L4(21, 4); const v4f l5 = GDN_L4(21, 5); __builtin_amdgcn_sched_barrier(0); x21 -= l0.x * x0; x21 -= l0.y * x1; x21 -= l0.z * x2; x21 -= l0.w * x3; x21 -= l1.x * x4; x21 -= l1.y * x5; x21 -= l1.z * x6; x21 -= l1.w * x7; x21 -= l2.x * x8; x21 -= l2.y * x9; x21 -= l2.z * x10; x21 -= l2.w * x11; x21 -= l3.x * x12; x21 -= l3.y * x13; x21 -= l3.z * x14; x21 -= l3.w * x15; x21 -= l4.x * x16; x21 -= l4.y * x17; x21 -= l4.z * x18; x21 -= l4.w * x19; x21 -= l5.x * x20; } __builtin_amdgcn_sched_barrier(0);
        float x22 = GDN_RHS(22); { const v4f l0 = GDN_L4(22, 0); const v4f l1 = GDN_L4(22, 1); const v4f l2 = GDN_L4(22, 2); const v4f l3 = GDN_L4(22, 3); const v4f l4 = GDN_L4(22, 4); const v4f l5 = GDN_L4(22, 5); __builtin_amdgcn_sched_barrier(0); x22 -= l0.x * x0; x22 -= l0.y * x1; x22 -= l0.z * x2; x22 -= l0.w * x3; x22 -= l1.x * x4; x22 -= l1.y * x5; x22 -= l1.z * x6; x22 -= l1.w * x7; x22 -= l2.x * x8; x22 -= l2.y * x9; x22 -= l2.z * x10; x22 -= l2.w * x11; x22 -= l3.x * x12; x22 -= l3.y * x13; x22 -= l3.z * x14; x22 -= l3.w * x15; x22 -= l4.x * x16; x22 -= l4.y * x17; x22 -= l4.z * x18; x22 -= l4.w * x19; x22 -= l5.x * x20; x22 -= l5.y * x21; } __builtin_amdgcn_sched_barrier(0);
        float x23 = GDN_RHS(23); { const v4f l0 = GDN_L4(23, 0); const v4f l1 = GDN_L4(23, 1); const v4f l2 = GDN_L4(23, 2); const v4f l3 = GDN_L4(23, 3); const v4f l4 = GDN_L4(23, 4); const v4f l5 = GDN_L4(23, 5); __builtin_amdgcn_sched_barrier(0); x23 -= l0.x * x0; x23 -= l0.y * x1; x23 -= l0.z * x2; x23 -= l0.w * x3; x23 -= l1.x * x4; x23 -= l1.y * x5; x23 -= l1.z * x6; x23 -= l1.w * x7; x23 -= l2.x * x8; x23 -= l2.y * x9; x23 -= l2.z * x10; x23 -= l2.w * x11; x23 -= l3.x * x12; x23 -= l3.y * x13; x23 -= l3.z * x14; x23 -= l3.w * x15; x23 -= l4.x * x16; x23 -= l4.y * x17; x23 -= l4.z * x18; x23 -= l4.w * x19; x23 -= l5.x * x20; x23 -= l5.y * x21; x23 -= l5.z * x22; } __builtin_amdgcn_sched_barrier(0);
        float x24 = GDN_RHS(24); { const v4f l0 = GDN_L4(24, 0); const v4f l1 = GDN_L4(24, 1); const v4f l2 = GDN_L4(24, 2); const v4f l3 = GDN_L4(24, 3); const v4f l4 = GDN_L4(24, 4); const v4f l5 = GDN_L4(24, 5); __builtin_amdgcn_sched_barrier(0); x24 -= l0.x * x0; x24 -= l0.y * x1; x24 -= l0.z * x2; x24 -= l0.w * x3; x24 -= l1.x * x4; x24 -= l1.y * x5; x24 -= l1.z * x6; x24 -= l1.w * x7; x24 -= l2.x * x8; x24 -= l2.y * x9; x24 -= l2.z * x10; x24 -= l2.w * x11; x24 -= l3.x * x12; x24 -= l3.y * x13; x24 -= l3.z * x14; x24 -= l3.w * x15; x24 -= l4.x * x16; x24 -= l4.y * x17; x24 -= l4.z * x18; x24 -= l4.w * x19; x24 -= l5.x * x20; x24 -= l5.y * x21; x24 -= l5.z * x22; x24 -= l5.w * x23; } __builtin_amdgcn_sched_barrier(0);
        float x25 = GDN_RHS(25); { const v4f l0 = GDN_L4(25, 0); const v4f l1 = GDN_L4(25, 1); const v4f l2 = GDN_L4(25, 2); const v4f l3 = GDN_L4(25, 3); const v4f l4 = GDN_L4(25, 4); const v4f l5 = GDN_L4(25, 5); __builtin_amdgcn_sched_barrier(0); x25 -= l0.x * x0; x25 -= l0.y * x1; x25 -= l0.z * x2; x25 -= l0.w * x3; x25 -= l1.x * x4; x25 -= l1.y * x5; x25 -= l1.z * x6; x25 -= l1.w * x7; x25 -= l2.x * x8; x25 -= l2.y * x9; x25 -= l2.z * x10; x25 -= l2.w * x11; x25 -= l3.x * x12; x25 -= l3.y * x13; x25 -= l3.z * x14; x25 -= l3.w * x15; x25 -= l4.x * x16; x25 -= l4.y * x17; x25 -= l4.z * x18; x25 -= l4.w * x19; x25 -= l5.x * x20; x25 -= l5.y * x21; x25 -= l5.z * x22; x25 -= l5.w * x23; } __builtin_amdgcn_sched_barrier(0); { const v4f l6 = GDN_L4(25, 6); __builtin_amdgcn_sched_barrier(0); x25 -= l6.x * x24; } __builtin_amdgcn_sched_barrier(0);
        float x26 = GDN_RHS(26); { const v4f l0 = GDN_L4(26, 0); const v4f l1 = GDN_L4(26, 1); const v4f l2 = GDN_L4(26, 2); const v4f l3 = GDN_L4(26, 3); const v4f l4 = GDN_L4(26, 4); const v4f l5 = GDN_L4(26, 5); __builtin_amdgcn_sched_barrier(0); x26 -= l0.x * x0; x26 -= l0.y * x1; x26 -= l0.z * x2; x26 -= l0.w * x3; x26 -= l1.x * x4; x26 -= l1.y * x5; x26 -= l1.z * x6; x26 -= l1.w * x7; x26 -= l2.x * x8; x26 -= l2.y * x9; x26 -= l2.z * x10; x26 -= l2.w * x11; x26 -= l3.x * x12; x26 -= l3.y * x13; x26 -= l3.z * x14; x26 -= l3.w * x15; x26 -= l4.x * x16; x26 -= l4.y * x17; x26 -= l4.z * x18; x26 -= l4.w * x19; x26 -= l5.x * x20; x26 -= l5.y * x21; x26 -= l5.z * x22; x26 -= l5.w * x23; } __builtin_amdgcn_sched_barrier(0); { const v4f l6 = GDN_L4(26, 6); __builtin_amdgcn_sched_barrier(0); x26 -= l6.x * x24; x26 -= l6.y * x25; } __builtin_amdgcn_sched_barrier(0);
        float x27 = GDN_RHS(27); { const v4f l0 = GDN_L4(27, 0); const v4f l1 = GDN_L4(27, 1); const v4f l2 = GDN_L4(27, 2); const v4f l3 = GDN_L4(27, 3); const v4f l4 = GDN_L4(27, 4); const v4f l5 = GDN_L4(27, 5); __builtin_amdgcn_sched_barrier(0); x27 -= l0.x * x0; x27 -= l0.y * x1; x27 -= l0.z * x2; x27 -= l0.w * x3; x27 -= l1.x * x4; x27 -= l1.y * x5; x27 -= l1.z * x6; x27 -= l1.w * x7; x27 -= l2.x * x8; x27 -= l2.y * x9; x27 -= l2.z * x10; x27 -= l2.w * x11; x27 -= l3.x * x12; x27 -= l3.y * x13; x27 -= l3.z * x14; x27 -= l3.w * x15; x27 -= l4.x * x16; x27 -= l4.y * x17; x27 -= l4.z * x18; x27 -= l4.w * x19; x27 -= l5.x * x20; x27 -= l5.y * x21; x27 -= l5.z * x22; x27 -= l5.w * x23; } __builtin_amdgcn_sched_barrier(0); { const v4f l6 = GDN_L4(27, 6); __builtin_amdgcn_sched_barrier(0); x27 -= l6.x * x24; x27 -= l6.y * x25; x27 -= l6.z * x26; } __builtin_amdgcn_sched_barrier(0);
        float x28 = GDN_RHS(28); { const v4f l0 = GDN_L4(28, 0); const v4f l1 = GDN_L4(28, 1); const v4f l2 = GDN_L4(28, 2); const v4f l3 = GDN_L4(28, 3); const v4f l4 = GDN_L4(28, 4); const v4f l5 = GDN_L4(28, 5); __builtin_amdgcn_sched_barrier(0); x28 -= l0.x * x0; x28 -= l0.y * x1; x28 -= l0.z * x2; x28 -= l0.w * x3; x28 -= l1.x * x4; x28 -= l1.y * x5; x28 -= l1.z * x6; x28 -= l1.w * x7; x28 -= l2.x * x8; x28 -= l2.y * x9; x28 -= l2.z * x10; x28 -= l2.w * x11; x28 -= l3.x * x12; x28 -= l3.y * x13; x28 -= l3.z * x14; x28 -= l3.w * x15; x28 -= l4.x * x16; x28 -= l4.y * x17; x28 -= l4.z * x18; x28 -= l4.w * x19; x28 -= l5.x * x20; x28 -= l5.y * x21; x28 -= l5.z * x22; x28 -= l5.w * x23; } __builtin_amdgcn_sched_barrier(0); { const v4f l6 = GDN_L4(28, 6); __builtin_amdgcn_sched_barrier(0); x28 -= l6.x * x24; x28 -= l6.y * x25; x28 -= l6.z * x26; x28 -= l6.w * x27; } __builtin_amdgcn_sched_barrier(0);
        float x29 = GDN_RHS(29); { const v4f l0 = GDN_L4(29, 0); const v4f l1 = GDN_L4(29, 1); const v4f l2 = GDN_L4(29, 2); const v4f l3 = GDN_L4(29, 3); const v4f l4 = GDN_L4(29, 4); const v4f l5 = GDN_L4(29, 5); __builtin_amdgcn_sched_barrier(0); x29 -= l0.x * x0; x29 -= l0.y * x1; x29 -= l0.z * x2; x29 -= l0.w * x3; x29 -= l1.x * x4; x29 -= l1.y * x5; x29 -= l1.z * x6; x29 -= l1.w * x7; x29 -= l2.x * x8; x29 -= l2.y * x9; x29 -= l2.z * x10; x29 -= l2.w * x11; x29 -= l3.x * x12; x29 -= l3.y * x13; x29 -= l3.z * x14; x29 -= l3.w * x15; x29 -= l4.x * x16; x29 -= l4.y * x17; x29 -= l4.z * x18; x29 -= l4.w * x19; x29 -= l5.x * x20; x29 -= l5.y * x21; x29 -= l5.z * x22; x29 -= l5.w * x23; } __builtin_amdgcn_sched_barrier(0); { const v4f l6 = GDN_L4(29, 6); const v4f l7 = GDN_L4(29, 7); __builtin_amdgcn_sched_barrier(0); x29 -= l6.x * x24; x29 -= l6.y * x25; x29 -= l6.z * x26; x29 -= l6.w * x27; x29 -= l7.x * x28; } __builtin_amdgcn_sched_barrier(0);
        float x30 = GDN_RHS(30); { const v4f l0 = GDN_L4(30, 0); const v4f l1 = GDN_L4(30, 1); const v4f l2 = GDN_L4(30, 2); const v4f l3 = GDN_L4(30, 3); const v4f l4 = GDN_L4(30, 4); const v4f l5 = GDN_L4(30, 5); __builtin_amdgcn_sched_barrier(0); x30 -= l0.x * x0; x30 -= l0.y * x1; x30 -= l0.z * x2; x30 -= l0.w * x3; x30 -= l1.x * x4; x30 -= l1.y * x5; x30 -= l1.z * x6; x30 -= l1.w * x7; x30 -= l2.x * x8; x30 -= l2.y * x9; x30 -= l2.z * x10; x30 -= l2.w * x11; x30 -= l3.x * x12; x30 -= l3.y * x13; x30 -= l3.z * x14; x30 -= l3.w * x15; x30 -= l4.x * x16; x30 -= l4.y * x17; x30 -= l4.z * x18; x30 -= l4.w * x19; x30 -= l5.x * x20; x30 -= l5.y * x21; x30 -= l5.z * x22; x30 -= l5.w * x23; } __builtin_amdgcn_sched_barrier(0); { const v4f l6 = GDN_L4(30, 6); const v4f l7 = GDN_L4(30, 7); __builtin_amdgcn_sched_barrier(0); x30 -= l6.x * x24; x30 -= l6.y * x25; x30 -= l6.z * x26; x30 -= l6.w * x27; x30 -= l7.x * x28; x30 -= l7.y * x29; } __builtin_amdgcn_sched_barrier(0);
        float x31 = GDN_RHS(31); { const v4f l0 = GDN_L4(31, 0); const v4f l1 = GDN_L4(31, 1); const v4f l2 = GDN_L4(31, 2); const v4f l3 = GDN_L4(31, 3); const v4f l4 = GDN_L4(31, 4); const v4f l5 = GDN_L4(31, 5); __builtin_amdgcn_sched_barrier(0); x31 -= l0.x * x0; x31 -= l0.y * x1; x31 -= l0.z * x2; x31 -= l0.w * x3; x31 -= l1.x * x4; x31 -= l1.y * x5; x31 -= l1.z * x6; x31 -= l1.w * x7; x31 -= l2.x * x8; x31 -= l2.y * x9; x31 -= l2.z * x10; x31 -= l2.w * x11; x31 -= l3.x * x12; x31 -= l3.y * x13; x31 -= l3.z * x14; x31 -= l3.w * x15; x31 -= l4.x * x16; x31 -= l4.y * x17; x31 -= l4.z * x18; x31 -= l4.w * x19; x31 -= l5.x * x20; x31 -= l5.y * x21; x31 -= l5.z * x22; x31 -= l5.w * x23; } __builtin_amdgcn_sched_barrier(0); { const v4f l6 = GDN_L4(31, 6); const v4f l7 = GDN_L4(31, 7); __builtin_amdgcn_sched_barrier(0); x31 -= l6.x * x24; x31 -= l6.y * x25; x31 -= l6.z * x26; x31 -= l6.w * x27; x31 -= l7.x * x28; x31 -= l7.y * x29; x31 -= l7.z * x30; } __builtin_amdgcn_sched_barrier(0);
        float x32 = GDN_RHS(32); { const v4f l0 = GDN_L4(32, 0); const v4f l1 = GDN_L4(32, 1); const v4f l2 = GDN_L4(32, 2); const v4f l3 = GDN_L4(32, 3); const v4f l4 = GDN_L4(32, 4); const v4f l5 = GDN_L4(32, 5); __builtin_amdgcn_sched_barrier(0); x32 -= l0.x * x0; x32 -= l0.y * x1; x32 -= l0.z * x2; x32 -= l0.w * x3; x32 -= l1.x * x4; x32 -= l1.y * x5; x32 -= l1.z * x6; x32 -= l1.w * x7; x32 -= l2.x * x8; x32 -= l2.y * x9; x32 -= l2.z * x10; x32 -= l2.w * x11; x32 -= l3.x * x12; x32 -= l3.y * x13; x32 -= l3.z * x14; x32 -= l3.w * x15; x32 -= l4.x * x16; x32 -= l4.y * x17; x32 -= l4.z * x18; x32 -= l4.w * x19; x32 -= l5.x * x20; x32 -= l5.y * x21; x32 -= l5.z * x22; x32 -= l5.w * x23; } __builtin_amdgcn_sched_barrier(0); { const v4f l6 = GDN_L4(32, 6); const v4f l7 = GDN_L4(32, 7); __builtin_amdgcn_sched_barrier(0); x32 -= l6.x * x24; x32 -= l6.y * x25; x32 -= l6.z * x26; x32 -= l6.w * x27; x32 -= l7.x * x28; x32 -= l7.y * x29; x32 -= l7.z * x30; x32 -= l7.w * x31; } __builtin_amdgcn_sched_barrier(0);
        float x33 = GDN_RHS(33); { const v4f l0 = GDN_L4(33, 0); const v4f l1 = GDN_L4(33, 1); const v4f l2 = GDN_L4(33, 2); const v4f l3 = GDN_L4(33, 3); const v4f l4 = GDN_L4(33, 4); const v4f l5 = GDN_L4(33, 5); __builtin_amdgcn_sched_barrier(0); x33 -= l0.x * x0; x33 -= l0.y * x1; x33 -= l0.z * x2; x33 -= l0.w * x3; x33 -= l1.x * x4; x33 -= l1.y * x5; x33 -= l1.z * x6; x33 -= l1.w * x7; x33 -= l2.x * x8; x33 -= l2.y * x9; x33 -= l2.z * x10; x33 -= l2.w * x11; x33 -= l3.x * x12; x33 -= l3.y * x13; x33 -= l3.z * x14; x33 -= l3.w * x15; x33 -= l4.x * x16; x33 -= l4.y * x17; x33 -= l4.z * x18; x33 -= l4.w * x19; x33 -= l5.x * x20; x33 -= l5.y * x21; x33 -= l5.z * x22; x33 -= l5.w * x23; } __builtin_amdgcn_sched_barrier(0); { const v4f l6 = GDN_L4(33, 6); const v4f l7 = GDN_L4(33, 7); const v4f l8 = GDN_L4(33, 8); __builtin_amdgcn_sched_barrier(0); x33 -= l6.x * x24; x33 -= l6.y * x25; x33 -= l6.z * x26; x33 -= l6.w * x27; x33 -= l7.x * x28; x33 -= l7.y * x29; x33 -= l7.z * x30; x33 -= l7.w * x31; x33 -= l8.x * x32; } __builtin_amdgcn_sched_barrier(0);
        float x34 = GDN_RHS(34); { const v4f l0 = GDN_L4(34, 0); const v4f l1 = GDN_L4(34, 1); const v4f l2 = GDN_L4(34, 2); const v4f l3 = GDN_L4(34, 3); const v4f l4 = GDN_L4(34, 4); const v4f l5 = GDN_L4(34, 5); __builtin_amdgcn_sched_barrier(0); x34 -= l0.x * x0; x34 -= l0.y * x1; x34 -= l0.z * x2; x34 -= l0.w * x3; x34 -= l1.x * x4; x34 -= l1.y * x5; x34 -= l1.z * x6; x34 -= l1.w * x7; x34 -= l2.x * x8; x34 -= l2.y * x9; x34 -= l2.z * x10; x34 -= l2.w * x11; x34 -= l3.x * x12; x34 -= l3.y * x13; x34 -= l3.z * x14; x34 -= l3.w * x15; x34 -= l4.x * x16; x34 -= l4.y * x17; x34 -= l4.z * x18; x34 -= l4.w * x19; x34 -= l5.x * x20; x34 -= l5.y * x21; x34 -= l5.z * x22; x34 -= l5.w * x23; } __builtin_amdgcn_sched_barrier(0); { const v4f l6 = GDN_L4(34, 6); const v4f l7 = GDN_L4(34, 7); const v4f l8 = GDN_L4(34, 8); __builtin_amdgcn_sched_barrier(0); x34 -= l6.x * x24; x34 -= l6.y * x25; x34 -= l6.z * x26; x34 -= l6.w * x27; x34 -= l7.x * x28; x34 -= l7.y * x29; x34 -= l7.z * x30; x34 -= l7.w * x31; x34 -= l8.x * x32; x34 -= l8.y * x33; } __builtin_amdgcn_sched_barrier(0);
        float x35 = GDN_RHS(35); { const v4f l0 = GDN_L4(35, 0); const v4f l1 = GDN_L4(35, 1); const v4f l2 = GDN_L4(35, 2); const v4f l3 = GDN_L4(35, 3); const v4f l4 = GDN_L4(35, 4); const v4f l5 = GDN_L4(35, 5); __builtin_amdgcn_sched_barrier(0); x35 -= l0.x * x0; x35 -= l0.y * x1; x35 -= l0.z * x2; x35 -= l0.w * x3; x35 -= l1.x * x4; x35 -= l1.y * x5; x35 -= l1.z * x6; x35 -= l1.w * x7; x35 -= l2.x * x8; x35 -= l2.y * x9; x35 -= l2.z * x10; x35 -= l2.w * x11; x35 -= l3.x * x12; x35 -= l3.y * x13; x35 -= l3.z * x14; x35 -= l3.w * x15; x35 -= l4.x * x16; x35 -= l4.y * x17; x35 -= l4.z * x18; x35 -= l4.w * x19; x35 -= l5.x * x20; x35 -= l5.y * x21; x35 -= l5.z * x22; x35 -= l5.w * x23; } __builtin_amdgcn_sched_barrier(0); { const v4f l6 = GDN_L4(35, 6); const v4f l7 = GDN_L4(35, 7); const v4f l8 = GDN_L4(35, 8); __builtin_amdgcn_sched_barrier(0); x35 -= l6.x * x24; x35 -= l6.y * x25; x35 -= l6.z * x26; x35 -= l6.w * x27; x35 -= l7.x * x28; x35 -= l7.y * x29; x35 -= l7.z * x30; x35 -= l7.w * x31; x35 -= l8.x * x32; x35 -= l8.y * x33; x35 -= l8.z * x34; } __builtin_amdgcn_sched_barrier(0);
        float x36 = GDN_RHS(36); { const v4f l0 = GDN_L4(36, 0); const v4f l1 = GDN_L4(36, 1); const v4f l2 = GDN_L4(36, 2); const v4f l3 = GDN_L4(36, 3); const v4f l4 = GDN_L4(36, 4); const v4f l5 = GDN_L4(36, 5); __builtin_amdgcn_sched_barrier(0); x36 -= l0.x * x0; x36 -= l0.y * x1; x36 -= l0.z * x2; x36 -= l0.w * x3; x36 -= l1.x * x4; x36 -= l1.y * x5; x36 -= l1.z * x6; x36 -= l1.w * x7; x36 -= l2.x * x8; x36 -= l2.y * x9; x36 -= l2.z * x10; x36 -= l2.w * x11; x36 -= l3.x * x12; x36 -= l3.y * x13; x36 -= l3.z * x14; x36 -= l3.w * x15; x36 -= l4.x * x16; x36 -= l4.y * x17; x36 -= l4.z * x18; x36 -= l4.w * x19; x36 -= l5.x * x20; x36 -= l5.y * x21; x36 -= l5.z * x22; x36 -= l5.w * x23; } __builtin_amdgcn_sched_barrier(0); { const v4f l6 = GDN_L4(36, 6); const v4f l7 = GDN_L4(36, 7); const v4f l8 = GDN_L4(36, 8); __builtin_amdgcn_sched_barrier(0); x36 -= l6.x * x24; x36 -= l6.y * x25; x36 -= l6.z * x26; x36 -= l6.w * x27; x36 -= l7.x * x28; x36 -= l7.y * x29; x36 -= l7.z * x30; x36 -= l7.w * x31; x36 -= l8.x * x32; x36 -= l8.y * x33; x36 -= l8.z * x34; x36 -= l8.w * x35; } __builtin_amdgcn_sched_barrier(0);
        float x37 = GDN_RHS(37); { const v4f l0 = GDN_L4(37, 0); const v4f l1 = GDN_L4(37, 1); const v4f l2 = GDN_L4(37, 2); const v4f l3 = GDN_L4(37, 3); const v4f l4 = GDN_L4(37, 4); const v4f l5 = GDN_L4(37, 5); __builtin_amdgcn_sched_barrier(0); x37 -= l0.x * x0; x37 -= l0.y * x1; x37 -= l0.z * x2; x37 -= l0.w * x3; x37 -= l1.x * x4; x37 -= l1.y * x5; x37 -= l1.z * x6; x37 -= l1.w * x7; x37 -= l2.x * x8; x37 -= l2.y * x9; x37 -= l2.z * x10; x37 -= l2.w * x11; x37 -= l3.x * x12; x37 -= l3.y * x13; x37 -= l3.z * x14; x37 -= l3.w * x15; x37 -= l4.x * x16; x37 -= l4.y * x17; x37 -= l4.z * x18; x37 -= l4.w * x19; x37 -= l5.x * x20; x37 -= l5.y * x21; x37 -= l5.z * x22; x37 -= l5.w * x23; } __builtin_amdgcn_sched_barrier(0); { const v4f l6 = GDN_L4(37, 6); const v4f l7 = GDN_L4(37, 7); const v4f l8 = GDN_L4(37, 8); const v4f l9 = GDN_L4(37, 9); __builtin_amdgcn_sched_barrier(0); x37 -= l6.x * x24; x37 -= l6.y * x25; x37 -= l6.z * x26; x37 -= l6.w * x27; x37 -= l7.x * x28; x37 -= l7.y * x29; x37 -= l7.z * x30; x37 -= l7.w * x31; x37 -= l8.x * x32; x37 -= l8.y * x33; x37 -= l8.z * x34; x37 -= l8.w * x35; x37 -= l9.x * x36; } __builtin_amdgcn_sched_barrier(0);
        float x38 = GDN_RHS(38); { const v4f l0 = GDN_L4(38, 0); const v4f l1 = GDN_L4(38, 1); const v4f l2 = GDN_L4(38, 2); const v4f l3 = GDN_L4(38, 3); const v4f l4 = GDN_L4(38, 4); const v4f l5 = GDN_L4(38, 5); __builtin_amdgcn_sched_barrier(0); x38 -= l0.x * x0; x38 -= l0.y * x1; x38 -= l0.z * x2; x38 -= l0.w * x3; x38 -= l1.x * x4; x38 -= l1.y * x5; x38 -= l1.z * x6; x38 -= l1.w * x7; x38 -= l2.x * x8; x38 -= l2.y * x9; x38 -= l2.z * x10; x38 -= l2.w * x11; x38 -= l3.x * x12; x38 -= l3.y * x13; x38 -= l3.z * x14; x38 -= l3.w * x15; x38 -= l4.x * x16; x38 -= l4.y * x17; x38 -= l4.z * x18; x38 -= l4.w * x19; x38 -= l5.x * x20; x38 -= l5.y * x21; x38 -= l5.z * x22; x38 -= l5.w * x23; } __builtin_amdgcn_sched_barrier(0); { const v4f l6 = GDN_L4(38, 6); const v4f l7 = GDN_L4(38, 7); const v4f l8 = GDN_L4(38, 8); const v4f l9 = GDN_L4(38, 9); __builtin_amdgcn_sched_barrier(0); x38 -= l6.x * x24; x38 -= l6.y * x25; x38 -= l6.z * x26; x38 -= l6.w * x27; x38 -= l7.x * x28; x38 -= l7.y * x29; x38 -= l7.z * x30; x38 -= l7.w * x31; x38 -= l8.x * x32; x38 -= l8.y * x33; x38 -= l8.z * x34; x38 -= l8.w * x35; x38 -= l9.x * x36; x38 -= l9.y * x37; } __builtin_amdgcn_sched_barrier(0);
        float x39 = GDN_RHS(39); { const v4f l0 = GDN_L4(39, 0); const v4f l1 = GDN_L4(39, 1); const v4f l2 = GDN_L4(39, 2); const v4f l3 = GDN_L4(39, 3); const v4f l4 = GDN_L4(39, 4); const v4f l5 = GDN_L4(39, 5); __builtin_amdgcn_sched_barrier(0); x39 -= l0.x * x0; x39 -= l0.y * x1; x39 -= l0.z * x2; x39 -= l0.w * x3; x39 -= l1.x * x4; x39 -= l1.y * x5; x39 -= l1.z * x6; x39 -= l1.w * x7; x39 -= l2.x * x8; x39 -= l2.y * x9; x39 -= l2.z * x10; x39 -= l2.w * x11; x39 -= l3.x * x12; x39 -= l3.y * x13; x39 -= l3.z * x14; x39 -= l3.w * x15; x39 -= l4.x * x16; x39 -= l4.y * x17; x39 -= l4.z * x18; x39 -= l4.w * x19; x39 -= l5.x * x20; x39 -= l5.y * x21; x39 -= l5.z * x22; x39 -= l5.w * x23; } __builtin_amdgcn_sched_barrier(0); { const v4f l6 = GDN_L4(39, 6); const v4f l7 = GDN_L4(39, 7); const v4f l8 = GDN_L4(39, 8); const v4f l9 = GDN_L4(39, 9); __builtin_amdgcn_sched_barrier(0); x39 -= l6.x * x24; x39 -= l6.y * x25; x39 -= l6.z * x26; x39 -= l6.w * x27; x39 -= l7.x * x28; x39 -= l7.y * x29; x39 -= l7.z * x30; x39 -= l7.w * x31; x39 -= l8.x * x32; x39 -= l8.y * x33; x39 -= l8.z * x34; x39 -= l8.w * x35; x39 -= l9.x * x36; x39 -= l9.y * x37; x39 -= l9.z * x38; } __builtin_amdgcn_sched_barrier(0);
        float x40 = GDN_RHS(40); { const v4f l0 = GDN_L4(40, 0); const v4f l1 = GDN_L4(40, 1); const v4f l2 = GDN_L4(40, 2); const v4f l3 = GDN_L4(40, 3); const v4f l4 = GDN_L4(40, 4); const v4f l5 = GDN_L4(40, 5); __builtin_amdgcn_sched_barrier(0); x40 -= l0.x * x0; x40 -= l0.y * x1; x40 -= l0.z * x2; x40 -= l0.w * x3; x40 -= l1.x * x4; x40 -= l1.y * x5; x40 -= l1.z * x6; x40 -= l1.w * x7; x40 -= l2.x * x8; x40 -= l2.y * x9; x40 -= l2.z * x10; x40 -= l2.w * x11; x40 -= l3.x * x12; x40 -= l3.y * x13; x40 -= l3.z * x14; x40 -= l3.w * x15; x40 -= l4.x * x16; x40 -= l4.y * x17; x40 -= l4.z * x18; x40 -= l4.w * x19; x40 -= l5.x * x20; x40 -= l5.y * x21; x40 -= l5.z * x22; x40 -= l5.w * x23; } __builtin_amdgcn_sched_barrier(0); { const v4f l6 = GDN_L4(40, 6); const v4f l7 = GDN_L4(40, 7); const v4f l8 = GDN_L4(40, 8); const v4f l9 = GDN_L4(40, 9); __builtin_amdgcn_sched_barrier(0); x40 -= l6.x * x24; x40 -= l6.y * x25; x40 -= l6.z * x26; x40 -= l6.w * x27; x40 -= l7.x * x28; x40 -= l7.y * x29; x40 -= l7.z * x30; x40 -= l7.w * x31; x40 -= l8.x * x32; x40 -= l8.y * x33; x40 -= l8.z * x34; x40 -= l8.w * x35; x40 -= l9.x * x36; x40 -= l9.y * x37; x40 -= l9.z * x38; x40 -= l9.w * x39; } __builtin_amdgcn_sched_barrier(0);
        float x41 = GDN_RHS(41); { const v4f l0 = GDN_L4(41, 0); const v4f l1 = GDN_L4(41, 1); const v4f l2 = GDN_L4(41, 2); const v4f l3 = GDN_L4(41, 3); const v4f l4 = GDN_L4(41, 4); const v4f l5 = GDN_L4(41, 5); __builtin_amdgcn_sched_barrier(0); x41 -= l0.x * x0; x41 -= l0.y * x1; x41 -= l0.z * x2; x41 -= l0.w * x3; x41 -= l1.x * x4; x41 -= l1.y * x5; x41 -= l1.z * x6; x41 -= l1.w * x7; x41 -= l2.x * x8; x41 -= l2.y * x9; x41 -= l2.z * x10; x41 -= l2.w * x11; x41 -= l3.x * x12; x41 -= l3.y * x13; x41 -= l3.z * x14; x41 -= l3.w * x15; x41 -= l4.x * x16; x41 -= l4.y * x17; x41 -= l4.z * x18; x41 -= l4.w * x19; x41 -= l5.x * x20; x41 -= l5.y * x21; x41 -= l5.z * x22; x41 -= l5.w * x23; } __builtin_amdgcn_sched_barrier(0); { const v4f l6 = GDN_L4(41, 6); const v4f l7 = GDN_L4(41, 7); const v4f l8 = GDN_L4(41, 8); const v4f l9 = GDN_L4(41, 9); const v4f l10 = GDN_L4(41, 10); __builtin_amdgcn_sched_barrier(0); x41 -= l6.x * x24; x41 -= l6.y * x25; x41 -= l6.z * x26; x41 -= l6.w * x27; x41 -= l7.x * x28; x41 -= l7.y * x29; x41 -= l7.z * x30; x41 -= l7.w * x31; x41 -= l8.x * x32; x41 -= l8.y * x33; x41 -= l8.z * x34; x41 -= l8.w * x35; x41 -= l9.x * x36; x41 -= l9.y * x37; x41 -= l9.z * x38; x41 -= l9.w * x39; x41 -= l10.x * x40; } __builtin_amdgcn_sched_barrier(0);
        float x42 = GDN_RHS(42); { const v4f l0 = GDN_L4(42, 0); const v4f l1 = GDN_L4(42, 1); const v4f l2 = GDN_L4(42, 2); const v4f l3 = GDN_L4(42, 3); const v4f l4 = GDN_L4(42, 4); const v4f l5 = GDN_L4(42, 5); __builtin_amdgcn_sched_barrier(0); x42 -= l0.x * x0; x42 -= l0.y * x1; x42 -= l0.z * x2; x42 -= l0.w * x3; x42 -= l1.x * x4; x42 -= l1.y * x5; x42 -= l1.z * x6; x42 -= l1.w * x7; x42 -= l2.x * x8; x42 -= l2.y * x9; x42 -= l2.z * x10; x42 -= l2.w * x11; x42 -= l3.x * x12; x42 -= l3.y * x13; x42 -= l3.z * x14; x42 -= l3.w * x15; x42 -= l4.x * x16; x42 -= l4.y * x17; x42 -= l4.z * x18; x42 -= l4.w * x19; x42 -= l5.x * x20; x42 -= l5.y * x21; x42 -= l5.z * x22; x42 -= l5.w * x23; } __builtin_amdgcn_sched_barrier(0); { const v4f l6 = GDN_L4(42, 6); const v4f l7 = GDN_L4(42, 7); const v4f l8 = GDN_L4(42, 8); const v4f l9 = GDN_L4(42, 9); const v4f l10 = GDN_L4(42, 10); __builtin_amdgcn_sched_barrier(0); x42 -= l6.x * x24; x42 -= l6.y * x25; x42 -= l6.z * x26; x42 -= l6.w * x27; x42 -= l7.x * x28; x42 -= l7.y * x29; x42 -= l7.z * x30; x42 -= l7.w * x31; x42 -= l8.x * x32; x42 -= l8.y * x33; x42 -= l8.z * x34; x42 -= l8.w * x35; x42 -= l9.x * x36; x42 -= l9.y * x37; x42 -= l9.z * x38; x42 -= l9.w * x39; x42 -= l10.x * x40; x42 -= l10.y * x41; } __builtin_amdgcn_sched_barrier(0);
        float x43 = GDN_RHS(43); { const v4f l0 = GDN_L4(43, 0); const v4f l1 = GDN_L4(43, 1); const v4f l2 = GDN_L4(43, 2); const v4f l3 = GDN_L4(43, 3); const v4f l4 = GDN_L4(43, 4); const v4f l5 = GDN_L4(43, 5); __builtin_amdgcn_sched_barrier(0); x43 -= l0.x * x0; x43 -= l0.y * x1; x43 -= l0.z * x2; x43 -= l0.w * x3; x43 -= l1.x * x4; x43 -= l1.y * x5; x43 -= l1.z * x6; x43 -= l1.w * x7; x43 -= l2.x * x8; x43 -= l2.y * x9; x43 -= l2.z * x10; x43 -= l2.w * x11; x43 -= l3.x * x12; x43 -= l3.y * x13; x43 -= l3.z * x14; x43 -= l3.w * x15; x43 -= l4.x * x16; x43 -= l4.y * x17; x43 -= l4.z * x18; x43 -= l4.w * x19; x43 -= l5.x * x20; x43 -= l5.y * x21; x43 -= l5.z * x22; x43 -= l5.w * x23; } __builtin_amdgcn_sched_barrier(0); { const v4f l6 = GDN_L4(43, 6); const v4f l7 = GDN_L4(43, 7); const v4f l8 = GDN_L4(43, 8); const v4f l9 = GDN_L4(43, 9); const v4f l10 = GDN_L4(43, 10); __builtin_amdgcn_sched_barrier(0); x43 -= l6.x * x24; x43 -= l6.y * x25; x43 -= l6.z * x26; x43 -= l6.w * x27; x43 -= l7.x * x28; x43 -= l7.y * x29; x43 -= l7.z * x30; x43 -= l7.w * x31; x43 -= l8.x * x32; x43 -= l8.y * x33; x43 -= l8.z * x34; x43 -= l8.w * x35; x43 -= l9.x * x36; x43 -= l9.y * x37; x43 -= l9.z * x38; x43 -= l9.w * x39; x43 -= l10.x * x40; x43 -= l10.y * x41; x43 -= l10.z * x42; } __builtin_amdgcn_sched_barrier(0);
        float x44 = GDN_RHS(44); { const v4f l0 = GDN_L4(44, 0); const v4f l1 = GDN_L4(44, 1); const v4f l2 = GDN_L4(44, 2); const v4f l3 = GDN_L4(44, 3); const v4f l4 = GDN_L4(44, 4); const v4f l5 = GDN_L4(44, 5); __builtin_amdgcn_sched_barrier(0); x44 -= l0.x * x0; x44 -= l0.y * x1; x44 -= l0.z * x2; x44 -= l0.w * x3; x44 -= l1.x * x4; x44 -= l1.y * x5; x44 -= l1.z * x6; x44 -= l1.w * x7; x44 -= l2.x * x8; x44 -= l2.y * x9; x44 -= l2.z * x10; x44 -= l2.w * x11; x44 -= l3.x * x12; x44 -= l3.y * x13; x44 -= l3.z * x14; x44 -= l3.w * x15; x44 -= l4.x * x16; x44 -= l4.y * x17; x44 -= l4.z * x18; x44 -= l4.w * x19; x44 -= l5.x * x20; x44 -= l5.y * x21; x44 -= l5.z * x22; x44 -= l5.w * x23; } __builtin_amdgcn_sched_barrier(0); { const v4f l6 = GDN_L4(44, 6); const v4f l7 = GDN_L4(44, 7); const v4f l8 = GDN_L4(44, 8); const v4f l9 = GDN_L4(44, 9); const v4f l10 = GDN_L4(44, 10); __builtin_amdgcn_sched_barrier(0); x44 -= l6.x * x24; x44 -= l6.y * x25; x44 -= l6.z * x26; x44 -= l6.w * x27; x44 -= l7.x * x28; x44 -= l7.y * x29; x44 -= l7.z * x30; x44 -= l7.w * x31; x44 -= l8.x * x32; x44 -= l8.y * x33; x44 -= l8.z * x34; x44 -= l8.w * x35; x44 -= l9.x * x36; x44 -= l9.y * x37; x44 -= l9.z * x38; x44 -= l9.w * x39; x44 -= l10.x * x40; x44 -= l10.y * x41; x44 -= l10.z * x42; x44 -= l10.w * x43; } __builtin_amdgcn_sched_barrier(0);
        float x45 = GDN_RHS(45); { const v4f l0 = GDN_L4(45, 0); const v4f l1 = GDN_L4(45, 1); const v4f l2 = GDN_L4(45, 2); const v4f l3 = GDN_L4(45, 3); const v4f l4 = GDN_L4(45, 4); const v4f l5 = GDN_L4(45, 5); __builtin_amdgcn_sched_barrier(0); x45 -= l0.x * x0; x45 -= l0.y * x1; x45 -= l0.z * x2; x45 -= l0.w * x3; x45 -= l1.x * x4; x45 -= l1.y * x5; x45 -= l1.z * x6; x45 -= l1.w * x7; x45 -= l2.x * x8; x45 -= l2.y * x9; x45 -= l2.z * x10; x45 -= l2.w * x11; x45 -= l3.x * x12; x45 -= l3.y * x13; x45 -= l3.z * x14; x45 -= l3.w * x15; x45 -= l4.x * x16; x45 -= l4.y * x17; x45 -= l4.z * x18; x45 -= l4.w * x19; x45 -= l5.x * x20; x45 -= l5.y * x21; x45 -= l5.z * x22; x45 -= l5.w * x23; } __builtin_amdgcn_sched_barrier(0); { const v4f l6 = GDN_L4(45, 6); const v4f l7 = GDN_L4(45, 7); const v4f l8 = GDN_L4(45, 8); const v4f l9 = GDN_L4(45, 9); const v4f l10 = GDN_L4(45, 10); const v4f l11 = GDN_L4(45, 11); __builtin_amdgcn_sched_barrier(0); x45 -= l6.x * x24; x45 -= l6.y * x25; x45 -= l6.z * x26; x45 -= l6.w * x27; x45 -= l7.x * x28; x45 -= l7.y * x29; x45 -= l7.z * x30; x45 -= l7.w * x31; x45 -= l8.x * x32; x45 -= l8.y * x33; x45 -= l8.z * x34; x45 -= l8.w * x35; x45 -= l9.x * x36; x45 -= l9.y * x37; x45 -= l9.z * x38; x45 -= l9.w * x39; x45 -= l10.x * x40; x45 -= l10.y * x41; x45 -= l10.z * x42; x45 -= l10.w * x43; x45 -= l11.x * x44; } __builtin_amdgcn_sched_barrier(0);
        float x46 = GDN_RHS(46); { const v4f l0 = GDN_L4(46, 0); const v4f l1 = GDN_L4(46, 1); const v4f l2 = GDN_L4(46, 2); const v4f l3 = GDN_L4(46, 3); const v4f l4 = GDN_L4(46, 4); const v4f l5 = GDN_L4(46, 5); __builtin_amdgcn_sched_barrier(0); x46 -= l0.x * x0; x46 -= l0.y * x1; x46 -= l0.z * x2; x46 -= l0.w * x3; x46 -= l1.x * x4; x46 -= l1.y * x5; x46 -= l1.z * x6; x46 -= l1.w * x7; x46 -= l2.x * x8; x46 -= l2.y * x9; x46 -= l2.z * x10; x46 -= l2.w * x11; x46 -= l3.x * x12; x46 -= l3.y * x13; x46 -= l3.z * x14; x46 -= l3.w * x15; x46 -= l4.x * x16; x46 -= l4.y * x17; x46 -= l4.z * x18; x46 -= l4.w * x19; x46 -= l5.x * x20; x46 -= l5.y * x21; x46 -= l5.z * x22; x46 -= l5.w * x23; } __builtin_amdgcn_sched_barrier(0); { const v4f l6 = GDN_L4(46, 6); const v4f l7 = GDN_L4(46, 7); const v4f l8 = GDN_L4(46, 8); const v4f l9 = GDN_L4(46, 9); const v4f l10 = GDN_L4(46, 10); const v4f l11 = GDN_L4(46, 11); __builtin_amdgcn_sched_barrier(0); x46 -= l6.x * x24; x46 -= l6.y * x25; x46 -= l6.z * x26; x46 -= l6.w * x27; x46 -= l7.x * x28; x46 -= l7.y * x29; x46 -= l7.z * x30; x46 -= l7.w * x31; x46 -= l8.x * x32; x46 -= l8.y * x33; x46 -= l8.z * x34; x46 -= l8.w * x35; x46 -= l9.x * x36; x46 -= l9.y * x37; x46 -= l9.z * x38; x46 -= l9.w * x39; x46 -= l10.x * x40; x46 -= l10.y * x41; x46 -= l10.z * x42; x46 -= l10.w * x43; x46 -= l11.x * x44; x46 -= l11.y * x45; } __builtin_amdgcn_sched_barrier(0);
        float x47 = GDN_RHS(47); { const v4f l0 = GDN_L4(47, 0); const v4f l1 = GDN_L4(47, 1); const v4f l2 = GDN_L4(47, 2); const v4f l3 = GDN_L4(47, 3); const v4f l4 = GDN_L4(47, 4); const v4f l5 = GDN_L4(47, 5); __builtin_amdgcn_sched_barrier(0); x47 -= l0.x * x0; x47 -= l0.y * x1; x47 -= l0.z * x2; x47 -= l0.w * x3; x47 -= l1.x * x4; x47 -= l1.y * x5; x47 -= l1.z * x6; x47 -= l1.w * x7; x47 -= l2.x * x8; x47 -= l2.y * x9; x47 -= l2.z * x10; x47 -= l2.w * x11; x47 -= l3.x * x12; x47 -= l3.y * x13; x47 -= l3.z * x14; x47 -= l3.w * x15; x47 -= l4.x * x16; x47 -= l4.y * x17; x47 -= l4.z * x18; x47 -= l4.w * x19; x47 -= l5.x * x20; x47 -= l5.y * x21; x47 -= l5.z * x22; x47 -= l5.w * x23; } __builtin_amdgcn_sched_barrier(0); { const v4f l6 = GDN_L4(47, 6); const v4f l7 = GDN_L4(47, 7); const v4f l8 = GDN_L4(47, 8); const v4f l9 = GDN_L4(47, 9); const v4f l10 = GDN_L4(47, 10); const v4f l11 = GDN_L4(47, 11); __builtin_amdgcn_sched_barrier(0); x47 -= l6.x * x24; x47 -= l6.y * x25; x47 -= l6.z * x26; x47 -= l6.w * x27; x47 -= l7.x * x28; x47 -= l7.y * x29; x47 -= l7.z * x30; x47 -= l7.w * x31; x47 -= l8.x * x32; x47 -= l8.y * x33; x47 -= l8.z * x34; x47 -= l8.w * x35; x47 -= l9.x * x36; x47 -= l9.y * x37; x47 -= l9.z * x38; x47 -= l9.w * x39; x47 -= l10.x * x40; x47 -= l10.y * x41; x47 -= l10.z * x42; x47 -= l10.w * x43; x47 -= l11.x * x44; x47 -= l11.y * x45; x47 -= l11.z * x46; } __builtin_amdgcn_sched_barrier(0);
        float x48 = GDN_RHS(48); { const v4f l0 = GDN_L4(48, 0); const v4f l1 = GDN_L4(48, 1); const v4f l2 = GDN_L4(48, 2); const v4f l3 = GDN_L4(48, 3); const v4f l4 = GDN_L4(48, 4); const v4f l5 = GDN_L4(48, 5); __builtin_amdgcn_sched_barrier(0); x48 -= l0.x * x0; x48 -= l0.y * x1; x48 -= l0.z * x2; x48 -= l0.w * x3; x48 -= l1.x * x4; x48 -= l1.y * x5; x48 -= l1.z * x6; x48 -= l1.w * x7; x48 -= l2.x * x8; x48 -= l2.y * x9; x48 -= l2.z * x10; x48 -= l2.w * x11; x48 -= l3.x * x12; x48 -= l3.y * x13; x48 -= l3.z * x14; x48 -= l3.w * x15; x48 -= l4.x * x16; x48 -= l4.y * x17; x48 -= l4.z * x18; x48 -= l4.w * x19; x48 -= l5.x * x20; x48 -= l5.y * x21; x48 -= l5.z * x22; x48 -= l5.w * x23; } __builtin_amdgcn_sched_barrier(0); { const v4f l6 = GDN_L4(48, 6); const v4f l7 = GDN_L4(48, 7); const v4f l8 = GDN_L4(48, 8); const v4f l9 = GDN_L4(48, 9); const v4f l10 = GDN_L4(48, 10); const v4f l11 = GDN_L4(48, 11); __builtin_amdgcn_sched_barrier(0); x48 -= l6.x * x24; x48 -= l6.y * x25; x48 -= l6.z * x26; x48 -= l6.w * x27; x48 -= l7.x * x28; x48 -= l7.y * x29; x48 -= l7.z * x30; x48 -= l7.w * x31; x48 -= l8.x * x32; x48 -= l8.y * x33; x48 -= l8.z * x34; x48 -= l8.w * x35; x48 -= l9.x * x36; x48 -= l9.y * x37; x48 -= l9.z * x38; x48 -= l9.w * x39; x48 -= l10.x * x40; x48 -= l10.y * x41; x48 -= l10.z * x42; x48 -= l10.w * x43; x48 -= l11.x * x44; x48 -= l11.y * x45; x48 -= l11.z * x46; x48 -= l11.w * x47; } __builtin_amdgcn_sched_barrier(0);
        float x49 = GDN_RHS(49); { const v4f l0 = GDN_L4(49, 0); const v4f l1 = GDN_L4(49, 1); const v4f l2 = GDN_L4(49, 2); const v4f l3 = GDN_L4(49, 3); const v4f l4 = GDN_L4(49, 4); const v4f l5 = GDN_L4(49, 5); __builtin_amdgcn_sched_barrier(0); x49 -= l0.x * x0; x49 -= l0.y * x1; x49 -= l0.z * x2; x49 -= l0.w * x3; x49 -= l1.x * x4; x49 -= l1.y * x5; x49 -= l1.z * x6; x49 -= l1.w * x7; x49 -= l2.x * x8; x49 -= l2.y * x9; x49 -= l2.z * x10; x49 -= l2.w * x11; x49 -= l3.x * x12; x49 -= l3.y * x13; x49 -= l3.z * x14; x49 -= l3.w * x15; x49 -= l4.x * x16; x49 -= l4.y * x17; x49 -= l4.z * x18; x49 -= l4.w * x19; x49 -= l5.x * x20; x49 -= l5.y * x21; x49 -= l5.z * x22; x49 -= l5.w * x23; } __builtin_amdgcn_sched_barrier(0); { const v4f l6 = GDN_L4(49, 6); const v4f l7 = GDN_L4(49, 7); const v4f l8 = GDN_L4(49, 8); const v4f l9 = GDN_L4(49, 9); const v4f l10 = GDN_L4(49, 10); const v4f l11 = GDN_L4(49, 11); __builtin_amdgcn_sched_barrier(0); x49 -= l6.x * x24; x49 -= l6.y * x25; x49 -= l6.z * x26; x49 -= l6.w * x27; x49 -= l7.x * x28; x49 -= l7.y * x29; x49 -= l7.z * x30; x49 -= l7.w * x31; x49 -= l8.x * x32; x49 -= l8.y * x33; x49 -= l8.z * x34; x49 -= l8.w * x35; x49 -= l9.x * x36; x49 -= l9.y * x37; x49 -= l9.z * x38; x49 -= l9.w * x39; x49 -= l10.x * x40; x49 -= l10.y * x41; x49 -= l10.z * x42; x49 -= l10.w * x43; x49 -= l11.x * x44; x49 -= l11.y * x45; x49 -= l11.z * x46; x49 -= l11.w * x47; } __builtin_amdgcn_sched_barrier(0); { const v4f l12 = GDN_L4(49, 12); __builtin_amdgcn_sched_barrier(0); x49 -= l12.x * x48; } __builtin_amdgcn_sched_barrier(0);
        float x50 = GDN_RHS(50); { const v4f l0 = GDN_L4(50, 0); const v4f l1 = GDN_L4(50, 1); const v4f l2 = GDN_L4(50, 2); const v4f l3 = GDN_L4(50, 3); const v4f l4 = GDN_L4(50, 4); const v4f l5 = GDN_L4(50, 5); __builtin_amdgcn_sched_barrier(0); x50 -= l0.x * x0; x50 -= l0.y * x1; x50 -= l0.z * x2; x50 -= l0.w * x3; x50 -= l1.x * x4; x50 -= l1.y * x5; x50 -= l1.z * x6; x50 -= l1.w * x7; x50 -= l2.x * x8; x50 -= l2.y * x9; x50 -= l2.z * x10; x50 -= l2.w * x11; x50 -= l3.x * x12; x50 -= l3.y * x13; x50 -= l3.z * x14; x50 -= l3.w * x15; x50 -= l4.x * x16; x50 -= l4.y * x17; x50 -= l4.z * x18; x50 -= l4.w * x19; x50 -= l5.x * x20; x50 -= l5.y * x21; x50 -= l5.z * x22; x50 -= l5.w * x23; } __builtin_amdgcn_sched_barrier(0); { const v4f l6 = GDN_L4(50, 6); const v4f l7 = GDN_L4(50, 7); const v4f l8 = GDN_L4(50, 8); const v4f l9 = GDN_L4(50, 9); const v4f l10 = GDN_L4(50, 10); const v4f l11 = GDN_L4(50, 11); __builtin_amdgcn_sched_barrier(0); x50 -= l6.x * x24; x50 -= l6.y * x25; x50 -= l6.z * x26; x50 -= l6.w * x27; x50 -= l7.x * x28; x50 -= l7.y * x29; x50 -= l7.z * x30; x50 -= l7.w * x31; x50 -= l8.x * x32; x50 -= l8.y * x33; x50 -= l8.z * x34; x50 -= l8.w * x35; x50 -= l9.x * x36; x50 -= l9.y * x37; x50 -= l9.z * x38; x50 -= l9.w * x39; x50 -= l10.x * x40; x50 -= l10.y * x41; x50 -= l10.z * x42; x50 -= l10.w * x43; x50 -= l11.x * x44; x50 -= l11.y * x45; x50 -= l11.z * x46; x50 -= l11.w * x47; } __builtin_amdgcn_sched_barrier(0); { const v4f l12 = GDN_L4(50, 12); __builtin_amdgcn_sched_barrier(0); x50 -= l12.x * x48; x50 -= l12.y * x49; } __builtin_amdgcn_sched_barrier(0);
        float x51 = GDN_RHS(51); { const v4f l0 = GDN_L4(51, 0); const v4f l1 = GDN_L4(51, 1); const v4f l2 = GDN_L4(51, 2); const v4f l3 = GDN_L4(51, 3); const v4f l4 = GDN_L4(51, 4); const v4f l5 = GDN_L4(51, 5); __builtin_amdgcn_sched_barrier(0); x51 -= l0.x * x0; x51 -= l0.y * x1; x51 -= l0.z * x2; x51 -= l0.w * x3; x51 -= l1.x * x4; x51 -= l1.y * x5; x51 -= l1.z * x6; x51 -= l1.w * x7; x51 -= l2.x * x8; x51 -= l2.y * x9; x51 -= l2.z * x10; x51 -= l2.w * x11; x51 -= l3.x * x12; x51 -= l3.y * x13; x51 -= l3.z * x14; x51 -= l3.w * x15; x51 -= l4.x * x16; x51 -= l4.y * x17; x51 -= l4.z * x18; x51 -= l4.w * x19; x51 -= l5.x * x20; x51 -= l5.y * x21; x51 -= l5.z * x22; x51 -= l5.w * x23; } __builtin_amdgcn_sched_barrier(0); { const v4f l6 = GDN_L4(51, 6); const v4f l7 = GDN_L4(51, 7); const v4f l8 = GDN_L4(51, 8); const v4f l9 = GDN_L4(51, 9); const v4f l10 = GDN_L4(51, 10); const v4f l11 = GDN_L4(51, 11); __builtin_amdgcn_sched_barrier(0); x51 -= l6.x * x24; x51 -= l6.y * x25; x51 -= l6.z * x26; x51 -= l6.w * x27; x51 -= l7.x * x28; x51 -= l7.y * x29; x51 -= l7.z * x30; x51 -= l7.w * x31; x51 -= l8.x * x32; x51 -= l8.y * x33; x51 -= l8.z * x34; x51 -= l8.w * x35; x51 -= l9.x * x36; x51 -= l9.y * x37; x51 -= l9.z * x38; x51 -= l9.w * x39; x51 -= l10.x * x40; x51 -= l10.y * x41; x51 -= l10.z * x42; x51 -= l10.w * x43; x51 -= l11.x * x44; x51 -= l11.y * x45; x51 -= l11.z * x46; x51 -= l11.w * x47; } __builtin_amdgcn_sched_barrier(0); { const v4f l12 = GDN_L4(51, 12); __builtin_amdgcn_sched_barrier(0); x51 -= l12.x * x48; x51 -= l12.y * x49; x51 -= l12.z * x50; } __builtin_amdgcn_sched_barrier(0);
        float x52 = GDN_RHS(52); { const v4f l0 = GDN_L4(52, 0); const v4f l1 = GDN_L4(52, 1); const v4f l2 = GDN_L4(52, 2); const v4f l3 = GDN_L4(52, 3); const v4f l4 = GDN_L4(52, 4); const v4f l5 = GDN_L4(52, 5); __builtin_amdgcn_sched_barrier(0); x52 -= l0.x * x0; x52 -= l0.y * x1; x52 -= l0.z * x2; x52 -= l0.w * x3; x52 -= l1.x * x4; x52 -= l1.y * x5; x52 -= l1.z * x6; x52 -= l1.w * x7; x52 -= l2.x * x8; x52 -= l2.y * x9; x52 -= l2.z * x10; x52 -= l2.w * x11; x52 -= l3.x * x12; x52 -= l3.y * x13; x52 -= l3.z * x14; x52 -= l3.w * x15; x52 -= l4.x * x16; x52 -= l4.y * x17; x52 -= l4.z * x18; x52 -= l4.w * x19; x52 -= l5.x * x20; x52 -= l5.y * x21; x52 -= l5.z * x22; x52 -= l5.w * x23; } __builtin_amdgcn_sched_barrier(0); { const v4f l6 = GDN_L4(52, 6); const v4f l7 = GDN_L4(52, 7); const v4f l8 = GDN_L4(52, 8); const v4f l9 = GDN_L4(52, 9); const v4f l10 = GDN_L4(52, 10); const v4f l11 = GDN_L4(52, 11); __builtin_amdgcn_sched_barrier(0); x52 -= l6.x * x24; x52 -= l6.y * x25; x52 -= l6.z * x26; x52 -= l6.w * x27; x52 -= l7.x * x28; x52 -= l7.y * x29; x52 -= l7.z * x30; x52 -= l7.w * x31; x52 -= l8.x * x32; x52 -= l8.y * x33; x52 -= l8.z * x34; x52 -= l8.w * x35; x52 -= l9.x * x36; x52 -= l9.y * x37; x52 -= l9.z * x38; x52 -= l9.w * x39; x52 -= l10.x * x40; x52 -= l10.y * x41; x52 -= l10.z * x42; x52 -= l10.w * x43; x52 -= l11.x * x44; x52 -= l11.y * x45; x52 -= l11.z * x46; x52 -= l11.w * x47; } __builtin_amdgcn_sched_barrier(0); { const v4f l12 = GDN_L4(52, 12); __builtin_amdgcn_sched_barrier(0); x52 -= l12.x * x48; x52 -= l12.y * x49; x52 -= l12.z * x50; x52 -= l12.w * x51; } __builtin_amdgcn_sched_barrier(0);
        float x53 = GDN_RHS(53); { const v4f l0 = GDN_L4(53, 0); const v4f l1 = GDN_L4(53, 1); const v4f l2 = GDN_L4(53, 2); const v4f l3 = GDN_L4(53, 3); const v4f l4 = GDN_L4(53, 4); const v4f l5 = GDN_L4(53, 5); __builtin_amdgcn_sched_barrier(0); x53 -= l0.x * x0; x53 -= l0.y * x1; x53 -= l0.z * x2; x53 -= l0.w * x3; x53 -= l1.x * x4; x53 -= l1.y * x5; x53 -= l1.z * x6; x53 -= l1.w * x7; x53 -= l2.x * x8; x53 -= l2.y * x9; x53 -= l2.z * x10; x53 -= l2.w * x11; x53 -= l3.x * x12; x53 -= l3.y * x13; x53 -= l3.z * x14; x53 -= l3.w * x15; x53 -= l4.x * x16; x53 -= l4.y * x17; x53 -= l4.z * x18; x53 -= l4.w * x19; x53 -= l5.x * x20; x53 -= l5.y * x21; x53 -= l5.z * x22; x53 -= l5.w * x23; } __builtin_amdgcn_sched_barrier(0); { const v4f l6 = GDN_L4(53, 6); const v4f l7 = GDN_L4(53, 7); const v4f l8 = GDN_L4(53, 8); const v4f l9 = GDN_L4(53, 9); const v4f l10 = GDN_L4(53, 10); const v4f l11 = GDN_L4(53, 11); __builtin_amdgcn_sched_barrier(0); x53 -= l6.x * x24; x53 -= l6.y * x25; x53 -= l6.z * x26; x53 -= l6.w * x27; x53 -= l7.x * x28; x53 -= l7.y * x29; x53 -= l7.z * x30; x53 -= l7.w * x31; x53 -= l8.x * x32; x53 -= l8.y * x33; x53 -= l8.z * x34; x53 -= l8.w * x35; x53 -= l9.x * x36; x53 -= l9.y * x37; x53 -= l9.z * x38; x53 -= l9.w * x39; x53 -= l10.x * x40; x53 -= l10.y * x41; x53 -= l10.z * x42; x53 -= l10.w * x43; x53 -= l11.x * x44; x53 -= l11.y * x45; x53 -= l11.z * x46; x53 -= l11.w * x47; } __builtin_amdgcn_sched_barrier(0); { const v4f l12 = GDN_L4(53, 12); const v4f l13 = GDN_L4(53, 13); __builtin_amdgcn_sched_barrier(0); x53 -= l12.x * x48; x53 -= l12.y * x49; x53 -= l12.z * x50; x53 -= l12.w * x51; x53 -= l13.x * x52; } __builtin_amdgcn_sched_barrier(0);
        float x54 = GDN_RHS(54); { const v4f l0 = GDN_L4(54, 0); const v4f l1 = GDN_L4(54, 1); const v4f l2 = GDN_L4(54, 2); const v4f l3 = GDN_L4(54, 3); const v4f l4 = GDN_L4(54, 4); const v4f l5 = GDN_L4(54, 5); __builtin_amdgcn_sched_barrier(0); x54 -= l0.x * x0; x54 -= l0.y * x1; x54 -= l0.z * x2; x54 -= l0.w * x3; x54 -= l1.x * x4; x54 -= l1.y * x5; x54 -= l1.z * x6; x54 -= l1.w * x7; x54 -= l2.x * x8; x54 -= l2.y * x9; x54 -= l2.z * x10; x54 -= l2.w * x11; x54 -= l3.x * x12; x54 -= l3.y * x13; x54 -= l3.z * x14; x54 -= l3.w * x15; x54 -= l4.x * x16; x54 -= l4.y * x17; x54 -= l4.z * x18; x54 -= l4.w * x19; x54 -= l5.x * x20; x54 -= l5.y * x21; x54 -= l5.z * x22; x54 -= l5.w * x23; } __builtin_amdgcn_sched_barrier(0); { const v4f l6 = GDN_L4(54, 6); const v4f l7 = GDN_L4(54, 7); const v4f l8 = GDN_L4(54, 8); const v4f l9 = GDN_L4(54, 9); const v4f l10 = GDN_L4(54, 10); const v4f l11 = GDN_L4(54, 11); __builtin_amdgcn_sched_barrier(0); x54 -= l6.x * x24; x54 -= l6.y * x25; x54 -= l6.z * x26; x54 -= l6.w * x27; x54 -= l7.x * x28; x54 -= l7.y * x29; x54 -= l7.z * x30; x54 -= l7.w * x31; x54 -= l8.x * x32; x54 -= l8.y * x33; x54 -= l8.z * x34; x54 -= l8.w * x35; x54 -= l9.x * x36; x54 -= l9.y * x37; x54 -= l9.z * x38; x54 -= l9.w * x39; x54 -= l10.x * x40; x54 -= l10.y * x41; x54 -= l10.z * x42; x54 -= l10.w * x43; x54 -= l11.x * x44; x54 -= l11.y * x45; x54 -= l11.z * x46; x54 -= l11.w * x47; } __builtin_amdgcn_sched_barrier(0); { const v4f l12 = GDN_L4(54, 12); const v4f l13 = GDN_L4(54, 13); __builtin_amdgcn_sched_barrier(0); x54 -= l12.x * x48; x54 -= l12.y * x49; x54 -= l12.z * x50; x54 -= l12.w * x51; x54 -= l13.x * x52; x54 -= l13.y * x53; } __builtin_amdgcn_sched_barrier(0);
        float x55 = GDN_RHS(55); { const v4f l0 = GDN_L4(55, 0); const v4f l1 = GDN_L4(55, 1); const v4f l2 = GDN_L4(55, 2); const v4f l3 = GDN_L4(55, 3); const v4f l4 = GDN_L4(55, 4); const v4f l5 = GDN_L4(55, 5); __builtin_amdgcn_sched_barrier(0); x55 -= l0.x * x0; x55 -= l0.y * x1; x55 -= l0.z * x2; x55 -= l0.w * x3; x55 -= l1.x * x4; x55 -= l1.y * x5; x55 -= l1.z * x6; x55 -= l1.w * x7; x55 -= l2.x * x8; x55 -= l2.y * x9; x55 -= l2.z * x10; x55 -= l2.w * x11; x55 -= l3.x * x12; x55 -= l3.y * x13; x55 -= l3.z * x14; x55 -= l3.w * x15; x55 -= l4.x * x16; x55 -= l4.y * x17; x55 -= l4.z * x18; x55 -= l4.w * x19; x55 -= l5.x * x20; x55 -= l5.y * x21; x55 -= l5.z * x22; x55 -= l5.w * x23; } __builtin_amdgcn_sched_barrier(0); { const v4f l6 = GDN_L4(55, 6); const v4f l7 = GDN_L4(55, 7); const v4f l8 = GDN_L4(55, 8); const v4f l9 = GDN_L4(55, 9); const v4f l10 = GDN_L4(55, 10); const v4f l11 = GDN_L4(55, 11); __builtin_amdgcn_sched_barrier(0); x55 -= l6.x * x24; x55 -= l6.y * x25; x55 -= l6.z * x26; x55 -= l6.w * x27; x55 -= l7.x * x28; x55 -= l7.y * x29; x55 -= l7.z * x30; x55 -= l7.w * x31; x55 -= l8.x * x32; x55 -= l8.y * x33; x55 -= l8.z * x34; x55 -= l8.w * x35; x55 -= l9.x * x36; x55 -= l9.y * x37; x55 -= l9.z * x38; x55 -= l9.w * x39; x55 -= l10.x * x40; x55 -= l10.y * x41; x55 -= l10.z * x42; x55 -= l10.w * x43; x55 -= l11.x * x44; x55 -= l11.y * x45; x55 -= l11.z * x46; x55 -= l11.w * x47; } __builtin_amdgcn_sched_barrier(0); { const v4f l12 = GDN_L4(55, 12); const v4f l13 = GDN_L4(55, 13); __builtin_amdgcn_sched_barrier(0); x55 -= l12.x * x48; x55 -= l12.y * x49; x55 -= l12.z * x50; x55 -= l12.w * x51; x55 -= l13.x * x52; x55 -= l13.y * x53; x55 -= l13.z * x54; } __builtin_amdgcn_sched_barrier(0);
        float x56 = GDN_RHS(56); { const v4f l0 = GDN_L4(56, 0); const v4f l1 = GDN_L4(56, 1); const v4f l2 = GDN_L4(56, 2); const v4f l3 = GDN_L4(56, 3); const v4f l4 = GDN_L4(56, 4); const v4f l5 = GDN_L4(56, 5); __builtin_amdgcn_sched_barrier(0); x56 -= l0.x * x0; x56 -= l0.y * x1; x56 -= l0.z * x2; x56 -= l0.w * x3; x56 -= l1.x * x4; x56 -= l1.y * x5; x56 -= l1.z * x6; x56 -= l1.w * x7; x56 -= l2.x * x8; x56 -= l2.y * x9; x56 -= l2.z * x10; x56 -= l2.w * x11; x56 -= l3.x * x12; x56 -= l3.y * x13; x56 -= l3.z * x14; x56 -= l3.w * x15; x56 -= l4.x * x16; x56 -= l4.y * x17; x56 -= l4.z * x18; x56 -= l4.w * x19; x56 -= l5.x * x20; x56 -= l5.y * x21; x56 -= l5.z * x22; x56 -= l5.w * x23; } __builtin_amdgcn_sched_barrier(0); { const v4f l6 = GDN_L4(56, 6); const v4f l7 = GDN_L4(56, 7); const v4f l8 = GDN_L4(56, 8); const v4f l9 = GDN_L4(56, 9); const v4f l10 = GDN_L4(56, 10); const v4f l11 = GDN_L4(56, 11); __builtin_amdgcn_sched_barrier(0); x56 -= l6.x * x24; x56 -= l6.y * x25; x56 -= l6.z * x26; x56 -= l6.w * x27; x56 -= l7.x * x28; x56 -= l7.y * x29; x56 -= l7.z * x30; x56 -= l7.w * x31; x56 -= l8.x * x32; x56 -= l8.y * x33; x56 -= l8.z * x34; x56 -= l8.w * x35; x56 -= l9.x * x36; x56 -= l9.y * x37; x56 -= l9.z * x38; x56 -= l9.w * x39; x56 -= l10.x * x40; x56 -= l10.y * x41; x56 -= l10.z * x42; x56 -= l10.w * x43; x56 -= l11.x * x44; x56 -= l11.y * x45; x56 -= l11.z * x46; x56 -= l11.w * x47; } __builtin_amdgcn_sched_barrier(0); { const v4f l12 = GDN_L4(56, 12); const v4f l13 = GDN_L4(56, 13); __builtin_amdgcn_sched_barrier(0); x56 -= l12.x * x48; x56 -= l12.y * x49; x56 -= l12.z * x50; x56 -= l12.w * x51; x56 -= l13.x * x52; x56 -= l13.y * x53; x56 -= l13.z * x54; x56 -= l13.w * x55; } __builtin_amdgcn_sched_barrier(0);
        float x57 = GDN_RHS(57); { const v4f l0 = GDN_L4(57, 0); const v4f l1 = GDN_L4(57, 1); const v4f l2 = GDN_L4(57, 2); const v4f l3 = GDN_L4(57, 3); const v4f l4 = GDN_L4(57, 4); const v4f l5 = GDN_L4(57, 5); __builtin_amdgcn_sched_barrier(0); x57 -= l0.x * x0; x57 -= l0.y * x1; x57 -= l0.z * x2; x57 -= l0.w * x3; x57 -= l1.x * x4; x57 -= l1.y * x5; x57 -= l1.z * x6; x57 -= l1.w * x7; x57 -= l2.x * x8; x57 -= l2.y * x9; x57 -= l2.z * x10; x57 -= l2.w * x11; x57 -= l3.x * x12; x57 -= l3.y * x13; x57 -= l3.z * x14; x57 -= l3.w * x15; x57 -= l4.x * x16; x57 -= l4.y * x17; x57 -= l4.z * x18; x57 -= l4.w * x19; x57 -= l5.x * x20; x57 -= l5.y * x21; x57 -= l5.z * x22; x57 -= l5.w * x23; } __builtin_amdgcn_sched_barrier(0); { const v4f l6 = GDN_L4(57, 6); const v4f l7 = GDN_L4(57, 7); const v4f l8 = GDN_L4(57, 8); const v4f l9 = GDN_L4(57, 9); const v4f l10 = GDN_L4(57, 10); const v4f l11 = GDN_L4(57, 11); __builtin_amdgcn_sched_barrier(0); x57 -= l6.x * x24; x57 -= l6.y * x25; x57 -= l6.z * x26; x57 -= l6.w * x27; x57 -= l7.x * x28; x57 -= l7.y * x29; x57 -= l7.z * x30; x57 -= l7.w * x31; x57 -= l8.x * x32; x57 -= l8.y * x33; x57 -= l8.z * x34; x57 -= l8.w * x35; x57 -= l9.x * x36; x57 -= l9.y * x37; x57 -= l9.z * x38; x57 -= l9.w * x39; x57 -= l10.x * x40; x57 -= l10.y * x41; x57 -= l10.z * x42; x57 -= l10.w * x43; x57 -= l11.x * x44; x57 -= l11.y * x45; x57 -= l11.z * x46; x57 -= l11.w * x47; } __builtin_amdgcn_sched_barrier(0); { const v4f l12 = GDN_L4(57, 12); const v4f l13 = GDN_L4(57, 13); const v4f l14 = GDN_L4(57, 14); __builtin_amdgcn_sched_barrier(0); x57 -= l12.x * x48; x57 -= l12.y * x49; x57 -= l12.z * x50; x57 -= l12.w * x51; x57 -= l13.x * x52; x57 -= l13.y * x53; x57 -= l13.z * x54; x57 -= l13.w * x55; x57 -= l14.x * x56; } __builtin_amdgcn_sched_barrier(0);
        float x58 = GDN_RHS(58); { const v4f l0 = GDN_L4(58, 0); const v4f l1 = GDN_L4(58, 1); const v4f l2 = GDN_L4(58, 2); const v4f l3 = GDN_L4(58, 3); const v4f l4 = GDN_L4(58, 4); const v4f l5 = GDN_L4(58, 5); __builtin_amdgcn_sched_barrier(0); x58 -= l0.x * x0; x58 -= l0.y * x1; x58 -= l0.z * x2; x58 -= l0.w * x3; x58 -= l1.x * x4; x58 -= l1.y * x5; x58 -= l1.z * x6; x58 -= l1.w * x7; x58 -= l2.x * x8; x58 -= l2.y * x9; x58 -= l2.z * x10; x58 -= l2.w * x11; x58 -= l3.x * x12; x58 -= l3.y * x13; x58 -= l3.z * x14; x58 -= l3.w * x15; x58 -= l4.x * x16; x58 -= l4.y * x17; x58 -= l4.z * x18; x58 -= l4.w * x19; x58 -= l5.x * x20; x58 -= l5.y * x21; x58 -= l5.z * x22; x58 -= l5.w * x23; } __builtin_amdgcn_sched_barrier(0); { const v4f l6 = GDN_L4(58, 6); const v4f l7 = GDN_L4(58, 7); const v4f l8 = GDN_L4(58, 8); const v4f l9 = GDN_L4(58, 9); const v4f l10 = GDN_L4(58, 10); const v4f l11 = GDN_L4(58, 11); __builtin_amdgcn_sched_barrier(0); x58 -= l6.x * x24; x58 -= l6.y * x25; x58 -= l6.z * x26; x58 -= l6.w * x27; x58 -= l7.x * x28; x58 -= l7.y * x29; x58 -= l7.z * x30; x58 -= l7.w * x31; x58 -= l8.x * x32; x58 -= l8.y * x33; x58 -= l8.z * x34; x58 -= l8.w * x35; x58 -= l9.x * x36; x58 -= l9.y * x37; x58 -= l9.z * x38; x58 -= l9.w * x39; x58 -= l10.x * x40; x58 -= l10.y * x41; x58 -= l10.z * x42; x58 -= l10.w * x43; x58 -= l11.x * x44; x58 -= l11.y * x45; x58 -= l11.z * x46; x58 -= l11.w * x47; } __builtin_amdgcn_sched_barrier(0); { const v4f l12 = GDN_L4(58, 12); const v4f l13 = GDN_L4(58, 13); const v4f l14 = GDN_L4(58, 14); __builtin_amdgcn_sched_barrier(0); x58 -= l12.x * x48; x58 -= l12.y * x49; x58 -= l12.z * x50; x58 -= l12.w * x51; x58 -= l13.x * x52; x58 -= l13.y * x53; x58 -= l13.z * x54; x58 -= l13.w * x55; x58 -= l14.x * x56; x58 -= l14.y * x57; } __builtin_amdgcn_sched_barrier(0);
        float x59 = GDN_RHS(59); { const v4f l0 = GDN_L4(59, 0); const v4f l1 = GDN_L4(59, 1); const v4f l2 = GDN_L4(59, 2); const v4f l3 = GDN_L4(59, 3); const v4f l4 = GDN_L4(59, 4); const v4f l5 = GDN_L4(59, 5); __builtin_amdgcn_sched_barrier(0); x59 -= l0.x * x0; x59 -= l0.y * x1; x59 -= l0.z * x2; x59 -= l0.w * x3; x59 -= l1.x * x4; x59 -= l1.y * x5; x59 -= l1.z * x6; x59 -= l1.w * x7; x59 -= l2.x * x8; x59 -= l2.y * x9; x59 -= l2.z * x10; x59 -= l2.w * x11; x59 -= l3.x * x12; x59 -= l3.y * x13; x59 -= l3.z * x14; x59 -= l3.w * x15; x59 -= l4.x * x16; x59 -= l4.y * x17; x59 -= l4.z * x18; x59 -= l4.w * x19; x59 -= l5.x * x20; x59 -= l5.y * x21; x59 -= l5.z * x22; x59 -= l5.w * x23; } __builtin_amdgcn_sched_barrier(0); { const v4f l6 = GDN_L4(59, 6); const v4f l7 = GDN_L4(59, 7); const v4f l8 = GDN_L4(59, 8); const v4f l9 = GDN_L4(59, 9); const v4f l10 = GDN_L4(59, 10); const v4f l11 = GDN_L4(59, 11); __builtin_amdgcn_sched_barrier(0); x59 -= l6.x * x24; x59 -= l6.y * x25; x59 -= l6.z * x26; x59 -= l6.w * x27; x59 -= l7.x * x28; x59 -= l7.y * x29; x59 -= l7.z * x30; x59 -= l7.w * x31; x59 -= l8.x * x32; x59 -= l8.y * x33; x59 -= l8.z * x34; x59 -= l8.w * x35; x59 -= l9.x * x36; x59 -= l9.y * x37; x59 -= l9.z * x38; x59 -= l9.w * x39; x59 -= l10.x * x40; x59 -= l10.y * x41; x59 -= l10.z * x42; x59 -= l10.w * x43; x59 -= l11.x * x44; x59 -= l11.y * x45; x59 -= l11.z * x46; x59 -= l11.w * x47; } __builtin_amdgcn_sched_barrier(0); { const v4f l12 = GDN_L4(59, 12); const v4f l13 = GDN_L4(59, 13); const v4f l14 = GDN_L4(59, 14); __builtin_amdgcn_sched_barrier(0); x59 -= l12.x * x48; x59 -= l12.y * x49; x59 -= l12.z * x50; x59 -= l12.w * x51; x59 -= l13.x * x52; x59 -= l13.y * x53; x59 -= l13.z * x54; x59 -= l13.w * x55; x59 -= l14.x * x56; x59 -= l14.y * x57; x59 -= l14.z * x58; } __builtin_amdgcn_sched_barrier(0);
        float x60 = GDN_RHS(60); { const v4f l0 = GDN_L4(60, 0); const v4f l1 = GDN_L4(60, 1); const v4f l2 = GDN_L4(60, 2); const v4f l3 = GDN_L4(60, 3); const v4f l4 = GDN_L4(60, 4); const v4f l5 = GDN_L4(60, 5); __builtin_amdgcn_sched_barrier(0); x60 -= l0.x * x0; x60 -= l0.y * x1; x60 -= l0.z * x2; x60 -= l0.w * x3; x60 -= l1.x * x4; x60 -= l1.y * x5; x60 -= l1.z * x6; x60 -= l1.w * x7; x60 -= l2.x * x8; x60 -= l2.y * x9; x60 -= l2.z * x10; x60 -= l2.w * x11; x60 -= l3.x * x12; x60 -= l3.y * x13; x60 -= l3.z * x14; x60 -= l3.w * x15; x60 -= l4.x * x16; x60 -= l4.y * x17; x60 -= l4.z * x18; x60 -= l4.w * x19; x60 -= l5.x * x20; x60 -= l5.y * x21; x60 -= l5.z * x22; x60 -= l5.w * x23; } __builtin_amdgcn_sched_barrier(0); { const v4f l6 = GDN_L4(60, 6); const v4f l7 = GDN_L4(60, 7); const v4f l8 = GDN_L4(60, 8); const v4f l9 = GDN_L4(60, 9); const v4f l10 = GDN_L4(60, 10); const v4f l11 = GDN_L4(60, 11); __builtin_amdgcn_sched_barrier(0); x60 -= l6.x * x24; x60 -= l6.y * x25; x60 -= l6.z * x26; x60 -= l6.w * x27; x60 -= l7.x * x28; x60 -= l7.y * x29; x60 -= l7.z * x30; x60 -= l7.w * x31; x60 -= l8.x * x32; x60 -= l8.y * x33; x60 -= l8.z * x34; x60 -= l8.w * x35; x60 -= l9.x * x36; x60 -= l9.y * x37; x60 -= l9.z * x38; x60 -= l9.w * x39; x60 -= l10.x * x40; x60 -= l10.y * x41; x60 -= l10.z * x42; x60 -= l10.w * x43; x60 -= l11.x * x44; x60 -= l11.y * x45; x60 -= l11.z * x46; x60 -= l11.w * x47; } __builtin_amdgcn_sched_barrier(0); { const v4f l12 = GDN_L4(60, 12); const v4f l13 = GDN_L4(60, 13); const v4f l14 = GDN_L4(60, 14); __builtin_amdgcn_sched_barrier(0); x60 -= l12.x * x48; x60 -= l12.y * x49; x60 -= l12.z * x50; x60 -= l12.w * x51; x60 -= l13.x * x52; x60 -= l13.y * x53; x60 -= l13.z * x54; x60 -= l13.w * x55; x60 -= l14.x * x56; x60 -= l14.y * x57; x60 -= l14.z * x58; x60 -= l14.w * x59; } __builtin_amdgcn_sched_barrier(0);
        float x61 = GDN_RHS(61); { const v4f l0 = GDN_L4(61, 0); const v4f l1 = GDN_L4(61, 1); const v4f l2 = GDN_L4(61, 2); const v4f l3 = GDN_L4(61, 3); const v4f l4 = GDN_L4(61, 4); const v4f l5 = GDN_L4(61, 5); __builtin_amdgcn_sched_barrier(0); x61 -= l0.x * x0; x61 -= l0.y * x1; x61 -= l0.z * x2; x61 -= l0.w * x3; x61 -= l1.x * x4; x61 -= l1.y * x5; x61 -= l1.z * x6; x61 -= l1.w * x7; x61 -= l2.x * x8; x61 -= l2.y * x9; x61 -= l2.z * x10; x61 -= l2.w * x11; x61 -= l3.x * x12; x61 -= l3.y * x13; x61 -= l3.z * x14; x61 -= l3.w * x15; x61 -= l4.x * x16; x61 -= l4.y * x17; x61 -= l4.z * x18; x61 -= l4.w * x19; x61 -= l5.x * x20; x61 -= l5.y * x21; x61 -= l5.z * x22; x61 -= l5.w * x23; } __builtin_amdgcn_sched_barrier(0); { const v4f l6 = GDN_L4(61, 6); const v4f l7 = GDN_L4(61, 7); const v4f l8 = GDN_L4(61, 8); const v4f l9 = GDN_L4(61, 9); const v4f l10 = GDN_L4(61, 10); const v4f l11 = GDN_L4(61, 11); __builtin_amdgcn_sched_barrier(0); x61 -= l6.x * x24; x61 -= l6.y * x25; x61 -= l6.z * x26; x61 -= l6.w * x27; x61 -= l7.x * x28; x61 -= l7.y * x29; x61 -= l7.z * x30; x61 -= l7.w * x31; x61 -= l8.x * x32; x61 -= l8.y * x33; x61 -= l8.z * x34; x61 -= l8.w * x35; x61 -= l9.x * x36; x61 -= l9.y * x37; x61 -= l9.z * x38; x61 -= l9.w * x39; x61 -= l10.x * x40; x61 -= l10.y * x41; x61 -= l10.z * x42; x61 -= l10.w * x43; x61 -= l11.x * x44; x61 -= l11.y * x45; x61 -= l11.z * x46; x61 -= l11.w * x47; } __builtin_amdgcn_sched_barrier(0); { const v4f l12 = GDN_L4(61, 12); const v4f l13 = GDN_L4(61, 13); const v4f l14 = GDN_L4(61, 14); const v4f l15 = GDN_L4(61, 15); __builtin_amdgcn_sched_barrier(0); x61 -= l12.x * x48; x61 -= l12.y * x49; x61 -= l12.z * x50; x61 -= l12.w * x51; x61 -= l13.x * x52; x61 -= l13.y * x53; x61 -= l13.z * x54; x61 -= l13.w * x55; x61 -= l14.x * x56; x61 -= l14.y * x57; x61 -= l14.z * x58; x61 -= l14.w * x59; x61 -= l15.x * x60; } __builtin_amdgcn_sched_barrier(0);
        float x62 = GDN_RHS(62); { const v4f l0 = GDN_L4(62, 0); const v4f l1 = GDN_L4(62, 1); const v4f l2 = GDN_L4(62, 2); const v4f l3 = GDN_L4(62, 3); const v4f l4 = GDN_L4(62, 4); const v4f l5 = GDN_L4(62, 5); __builtin_amdgcn_sched_barrier(0); x62 -= l0.x * x0; x62 -= l0.y * x1; x62 -= l0.z * x2; x62 -= l0.w * x3; x62 -= l1.x * x4; x62 -= l1.y * x5; x62 -= l1.z * x6; x62 -= l1.w * x7; x62 -= l2.x * x8; x62 -= l2.y * x9; x62 -= l2.z * x10; x62 -= l2.w * x11; x62 -= l3.x * x12; x62 -= l3.y * x13; x62 -= l3.z * x14; x62 -= l3.w * x15; x62 -= l4.x * x16; x62 -= l4.y * x17; x62 -= l4.z * x18; x62 -= l4.w * x19; x62 -= l5.x * x20; x62 -= l5.y * x21; x62 -= l5.z * x22; x62 -= l5.w * x23; } __builtin_amdgcn_sched_barrier(0); { const v4f l6 = GDN_L4(62, 6); const v4f l7 = GDN_L4(62, 7); const v4f l8 = GDN_L4(62, 8); const v4f l9 = GDN_L4(62, 9); const v4f l10 = GDN_L4(62, 10); const v4f l11 = GDN_L4(62, 11); __builtin_amdgcn_sched_barrier(0); x62 -= l6.x * x24; x62 -= l6.y * x25; x62 -= l6.z * x26; x62 -= l6.w * x27; x62 -= l7.x * x28; x62 -= l7.y * x29; x62 -= l7.z * x30; x62 -= l7.w * x31; x62 -= l8.x * x32; x62 -= l8.y * x33; x62 -= l8.z * x34; x62 -= l8.w * x35; x62 -= l9.x * x36; x62 -= l9.y * x37; x62 -= l9.z * x38; x62 -= l9.w * x39; x62 -= l10.x * x40; x62 -= l10.y * x41; x62 -= l10.z * x42; x62 -= l10.w * x43; x62 -= l11.x * x44; x62 -= l11.y * x45; x62 -= l11.z * x46; x62 -= l11.w * x47; } __builtin_amdgcn_sched_barrier(0); { const v4f l12 = GDN_L4(62, 12); const v4f l13 = GDN_L4(62, 13); const v4f l14 = GDN_L4(62, 14); const v4f l15 = GDN_L4(62, 15); __builtin_amdgcn_sched_barrier(0); x62 -= l12.x * x48; x62 -= l12.y * x49; x62 -= l12.z * x50; x62 -= l12.w * x51; x62 -= l13.x * x52; x62 -= l13.y * x53; x62 -= l13.z * x54; x62 -= l13.w * x55; x62 -= l14.x * x56; x62 -= l14.y * x57; x62 -= l14.z * x58; x62 -= l14.w * x59; x62 -= l15.x * x60; x62 -= l15.y * x61; } __builtin_amdgcn_sched_barrier(0);
        float x63 = GDN_RHS(63); { const v4f l0 = GDN_L4(63, 0); const v4f l1 = GDN_L4(63, 1); const v4f l2 = GDN_L4(63, 2); const v4f l3 = GDN_L4(63, 3); const v4f l4 = GDN_L4(63, 4); const v4f l5 = GDN_L4(63, 5); __builtin_amdgcn_sched_barrier(0); x63 -= l0.x * x0; x63 -= l0.y * x1; x63 -= l0.z * x2; x63 -= l0.w * x3; x63 -= l1.x * x4; x63 -= l1.y * x5; x63 -= l1.z * x6; x63 -= l1.w * x7; x63 -= l2.x * x8; x63 -= l2.y * x9; x63 -= l2.z * x10; x63 -= l2.w * x11; x63 -= l3.x * x12; x63 -= l3.y * x13; x63 -= l3.z * x14; x63 -= l3.w * x15; x63 -= l4.x * x16; x63 -= l4.y * x17; x63 -= l4.z * x18; x63 -= l4.w * x19; x63 -= l5.x * x20; x63 -= l5.y * x21; x63 -= l5.z * x22; x63 -= l5.w * x23; } __builtin_amdgcn_sched_barrier(0); { const v4f l6 = GDN_L4(63, 6); const v4f l7 = GDN_L4(63, 7); const v4f l8 = GDN_L4(63, 8); const v4f l9 = GDN_L4(63, 9); const v4f l10 = GDN_L4(63, 10); const v4f l11 = GDN_L4(63, 11); __builtin_amdgcn_sched_barrier(0); x63 -= l6.x * x24; x63 -= l6.y * x25; x63 -= l6.z * x26; x63 -= l6.w * x27; x63 -= l7.x * x28; x63 -= l7.y * x29; x63 -= l7.z * x30; x63 -= l7.w * x31; x63 -= l8.x * x32; x63 -= l8.y * x33; x63 -= l8.z * x34; x63 -= l8.w * x35; x63 -= l9.x * x36; x63 -= l9.y * x37; x63 -= l9.z * x38; x63 -= l9.w * x39; x63 -= l10.x * x40; x63 -= l10.y * x41; x63 -= l10.z * x42; x63 -= l10.w * x43; x63 -= l11.x * x44; x63 -= l11.y * x45; x63 -= l11.z * x46; x63 -= l11.w * x47; } __builtin_amdgcn_sched_barrier(0); { const v4f l12 = GDN_L4(63, 12); const v4f l13 = GDN_L4(63, 13); const v4f l14 = GDN_L4(63, 14); const v4f l15 = GDN_L4(63, 15); __builtin_amdgcn_sched_barrier(0); x63 -= l12.x * x48; x63 -= l12.y * x49; x63 -= l12.z * x50; x63 -= l12.w * x51; x63 -= l13.x * x52; x63 -= l13.y * x53; x63 -= l13.z * x54; x63 -= l13.w * x55; x63 -= l14.x * x56; x63 -= l14.y * x57; x63 -= l14.z * x58; x63 -= l14.w * x59; x63 -= l15.x * x60; x63 -= l15.y * x61; x63 -= l15.z * x62; } __builtin_amdgcn_sched_barrier(0);
        if (c < 128) { GU[0 * 128 + c] = x0; GU[1 * 128 + c] = x1; GU[2 * 128 + c] = x2; GU[3 * 128 + c] = x3; GU[4 * 128 + c] = x4; GU[5 * 128 + c] = x5; GU[6 * 128 + c] = x6; GU[7 * 128 + c] = x7; GU[8 * 128 + c] = x8; GU[9 * 128 + c] = x9; GU[10 * 128 + c] = x10; GU[11 * 128 + c] = x11; GU[12 * 128 + c] = x12; GU[13 * 128 + c] = x13; GU[14 * 128 + c] = x14; GU[15 * 128 + c] = x15; GU[16 * 128 + c] = x16; GU[17 * 128 + c] = x17; GU[18 * 128 + c] = x18; GU[19 * 128 + c] = x19; GU[20 * 128 + c] = x20; GU[21 * 128 + c] = x21; GU[22 * 128 + c] = x22; GU[23 * 128 + c] = x23; GU[24 * 128 + c] = x24; GU[25 * 128 + c] = x25; GU[26 * 128 + c] = x26; GU[27 * 128 + c] = x27; GU[28 * 128 + c] = x28; GU[29 * 128 + c] = x29; GU[30 * 128 + c] = x30; GU[31 * 128 + c] = x31; GU[32 * 128 + c] = x32; GU[33 * 128 + c] = x33; GU[34 * 128 + c] = x34; GU[35 * 128 + c] = x35; GU[36 * 128 + c] = x36; GU[37 * 128 + c] = x37; GU[38 * 128 + c] = x38; GU[39 * 128 + c] = x39; GU[40 * 128 + c] = x40; GU[41 * 128 + c] = x41; GU[42 * 128 + c] = x42; GU[43 * 128 + c] = x43; GU[44 * 128 + c] = x44; GU[45 * 128 + c] = x45; GU[46 * 128 + c] = x46; GU[47 * 128 + c] = x47; GU[48 * 128 + c] = x48; GU[49 * 128 + c] = x49; GU[50 * 128 + c] = x50; GU[51 * 128 + c] = x51; GU[52 * 128 + c] = x52; GU[53 * 128 + c] = x53; GU[54 * 128 + c] = x54; GU[55 * 128 + c] = x55; GU[56 * 128 + c] = x56; GU[57 * 128 + c] = x57; GU[58 * 128 + c] = x58; GU[59 * 128 + c] = x59; GU[60 * 128 + c] = x60; GU[61 * 128 + c] = x61; GU[62 * 128 + c] = x62; GU[63 * 128 + c] = x63; }
        else { GNW[0 * 128 + (c - 128)] = (bf16)f2bf(-x0); GNW[1 * 128 + (c - 128)] = (bf16)f2bf(-x1); GNW[2 * 128 + (c - 128)] = (bf16)f2bf(-x2); GNW[3 * 128 + (c - 128)] = (bf16)f2bf(-x3); GNW[4 * 128 + (c - 128)] = (bf16)f2bf(-x4); GNW[5 * 128 + (c - 128)] = (bf16)f2bf(-x5); GNW[6 * 128 + (c - 128)] = (bf16)f2bf(-x6); GNW[7 * 128 + (c - 128)] = (bf16)f2bf(-x7); GNW[8 * 128 + (c - 128)] = (bf16)f2bf(-x8); GNW[9 * 128 + (c - 128)] = (bf16)f2bf(-x9); GNW[10 * 128 + (c - 128)] = (bf16)f2bf(-x10); GNW[11 * 128 + (c - 128)] = (bf16)f2bf(-x11); GNW[12 * 128 + (c - 128)] = (bf16)f2bf(-x12); GNW[13 * 128 + (c - 128)] = (bf16)f2bf(-x13); GNW[14 * 128 + (c - 128)] = (bf16)f2bf(-x14); GNW[15 * 128 + (c - 128)] = (bf16)f2bf(-x15); GNW[16 * 128 + (c - 128)] = (bf16)f2bf(-x16); GNW[17 * 128 + (c - 128)] = (bf16)f2bf(-x17); GNW[18 * 128 + (c - 128)] = (bf16)f2bf(-x18); GNW[19 * 128 + (c - 128)] = (bf16)f2bf(-x19); GNW[20 * 128 + (c - 128)] = (bf16)f2bf(-x20); GNW[21 * 128 + (c - 128)] = (bf16)f2bf(-x21); GNW[22 * 128 + (c - 128)] = (bf16)f2bf(-x22); GNW[23 * 128 + (c - 128)] = (bf16)f2bf(-x23); GNW[24 * 128 + (c - 128)] = (bf16)f2bf(-x24); GNW[25 * 128 + (c - 128)] = (bf16)f2bf(-x25); GNW[26 * 128 + (c - 128)] = (bf16)f2bf(-x26); GNW[27 * 128 + (c - 128)] = (bf16)f2bf(-x27); GNW[28 * 128 + (c - 128)] = (bf16)f2bf(-x28); GNW[29 * 128 + (c - 128)] = (bf16)f2bf(-x29); GNW[30 * 128 + (c - 128)] = (bf16)f2bf(-x30); GNW[31 * 128 + (c - 128)] = (bf16)f2bf(-x31); GNW[32 * 128 + (c - 128)] = (bf16)f2bf(-x32); GNW[33 * 128 + (c - 128)] = (bf16)f2bf(-x33); GNW[34 * 128 + (c - 128)] = (bf16)f2bf(-x34); GNW[35 * 128 + (c - 128)] = (bf16)f2bf(-x35); GNW[36 * 128 + (c - 128)] = (bf16)f2bf(-x36); GNW[37 * 128 + (c - 128)] = (bf16)f2bf(-x37); GNW[38 * 128 + (c - 128)] = (bf16)f2bf(-x38); GNW[39 * 128 + (c - 128)] = (bf16)f2bf(-x39); GNW[40 * 128 + (c - 128)] = (bf16)f2bf(-x40); GNW[41 * 128 + (c - 128)] = (bf16)f2bf(-x41); GNW[42 * 128 + (c - 128)] = (bf16)f2bf(-x42); GNW[43 * 128 + (c - 128)] = (bf16)f2bf(-x43); GNW[44 * 128 + (c - 128)] = (bf16)f2bf(-x44); GNW[45 * 128 + (c - 128)] = (bf16)f2bf(-x45); GNW[46 * 128 + (c - 128)] = (bf16)f2bf(-x46); GNW[47 * 128 + (c - 128)] = (bf16)f2bf(-x47); GNW[48 * 128 + (c - 128)] = (bf16)f2bf(-x48); GNW[49 * 128 + (c - 128)] = (bf16)f2bf(-x49); GNW[50 * 128 + (c - 128)] = (bf16)f2bf(-x50); GNW[51 * 128 + (c - 128)] = (bf16)f2bf(-x51); GNW[52 * 128 + (c - 128)] = (bf16)f2bf(-x52); GNW[53 * 128 + (c - 128)] = (bf16)f2bf(-x53); GNW[54 * 128 + (c - 128)] = (bf16)f2bf(-x54); GNW[55 * 128 + (c - 128)] = (bf16)f2bf(-x55); GNW[56 * 128 + (c - 128)] = (bf16)f2bf(-x56); GNW[57 * 128 + (c - 128)] = (bf16)f2bf(-x57); GNW[58 * 128 + (c - 128)] = (bf16)f2bf(-x58); GNW[59 * 128 + (c - 128)] = (bf16)f2bf(-x59); GNW[60 * 128 + (c - 128)] = (bf16)f2bf(-x60); GNW[61 * 128 + (c - 128)] = (bf16)f2bf(-x61); GNW[62 * 128 + (c - 128)] = (bf16)f2bf(-x62); GNW[63 * 128 + (c - 128)] = (bf16)f2bf(-x63); }
#undef GDN_RHS
#undef GDN_L4
    } else {
        const int t2 = tid - 256; const float gl = gcs[63];
        { const int i = t2 >> 2, d0 = (t2 & 3) * 32; const float e = __expf(gcs[i]);
#pragma unroll
          for (int x8 = 0; x8 < 4; ++x8) { const v4f a = *(const LAS v4f*)(qs + i * QP + d0 + 8 * x8), b = *(const LAS v4f*)(qs + i * QP + d0 + 8 * x8 + 4);
              v4u w; w.x = pk2(a.x * e, a.y * e); w.y = pk2(a.z * e, a.w * e); w.z = pk2(b.x * e, b.y * e); w.w = pk2(b.z * e, b.w * e); *(v4u*)(GQG + i * 128 + d0 + 8 * x8) = w; } }
        { const int d = t2 >> 1, j0 = (t2 & 1) * 32;
#pragma unroll
          for (int x8 = 0; x8 < 4; ++x8) { float o[8];
#pragma unroll
              for (int x = 0; x < 8; ++x) { const int j = j0 + 8 * x8 + x; o[x] = ks[j * QP + d] * __expf(gl - gcs[j]); }
              v4u w; w.x = pk2(o[0], o[1]); w.y = pk2(o[2], o[3]); w.z = pk2(o[4], o[5]); w.w = pk2(o[6], o[7]); *(v4u*)(GKT + d * 64 + j0 + 8 * x8) = w; } }
        if (t2 == 0) GDL[item] = __expf(gl);
    }
    __syncthreads();
}
struct GdnFrags { bf16x8_t nw[4], qg[4], at[2], kt[2][2]; float u[4]; float dl; };
__device__ __forceinline__ void gdn_load(GdnFrags& F, const Params& p, int item, int off128, int off64, int offk, int offu) {
    const bf16* GNW = (const bf16*)(p.ws + WS_GNW) + (size_t)item * 8192; const bf16* GQG = (const bf16*)(p.ws + WS_GQG) + (size_t)item * 8192;
    const bf16* GAT = (const bf16*)(p.ws + WS_GAT) + (size_t)item * 4096; const bf16* GKT = (const bf16*)(p.ws + WS_GKT) + (size_t)item * 8192; const float* GU = (const float*)(p.ws + WS_GU) + (size_t)item * 8192;
#pragma unroll
    for (int ks = 0; ks < 4; ++ks) { F.nw[ks] = *(const bf16x8_t*)(GNW + off128 + 32 * ks); F.qg[ks] = *(const bf16x8_t*)(GQG + off128 + 32 * ks); }
#pragma unroll
    for (int ks = 0; ks < 2; ++ks) { F.at[ks] = *(const bf16x8_t*)(GAT + off64 + 32 * ks); F.kt[0][ks] = *(const bf16x8_t*)(GKT + offk + 32 * ks); F.kt[1][ks] = *(const bf16x8_t*)(GKT + offk + 1024 + 32 * ks); }
#pragma unroll
    for (int r = 0; r < 4; ++r) F.u[r] = GU[offu + r * 128];
    F.dl = ((const float*)(p.ws + WS_GDL))[item];
}
constexpr int STP = 136, VNP = 72;
__device__ __forceinline__ void gdn_seq(const Params& p, LAS unsigned char* lds, int wgi, int wave, int lane) {
    const int u = wgi * 2 + (wave >> 2), wi = wave & 3, h = u >> 3, sl = u & 7, g = lane >> 4, c = lane & 15;
    LAS unsigned short* ST = (LAS unsigned short*)(lds + (wave >> 2) * 12288);
    LAS unsigned short* VNT = ST + 2 * 16 * STP;
    float* GO = (float*)(p.ws + WS_GO);
    const int off128 = (16 * wi + c) * 128 + 8 * g, off64 = (16 * wi + c) * 64 + 8 * g, offk = (32 * wi + c) * 64 + 8 * g, offu = (16 * wi + 4 * g) * 128 + 16 * sl + c;
#pragma unroll
    for (int mt = 0; mt < 2; ++mt) *(LAS v2u*)(ST + c * STP + 16 * (2 * wi + mt) + 4 * g) = (v2u){0u, 0u};
    pg8::f32x4 Sacc[2] = {{0.f, 0.f, 0.f, 0.f}, {0.f, 0.f, 0.f, 0.f}};
    __syncthreads();
    GdnFrags F0, F1;
    gdn_load(F0, p, h, off128, off64, offk, offu);
#define GDN_STEP(F, n_) do { const int cur = (n_) & 1; bf16x8_t sf[4]; \
        _Pragma("unroll") for (int ks = 0; ks < 4; ++ks) sf[ks] = *(const LAS bf16x8_t*)(ST + cur * 16 * STP + c * STP + 32 * ks + 8 * g); \
        pg8::f32x4 vn = {F.u[0], F.u[1], F.u[2], F.u[3]}; \
        _Pragma("unroll") for (int ks = 0; ks < 4; ++ks) vn = __builtin_amdgcn_mfma_f32_16x16x32_bf16(F.nw[ks], sf[ks], vn, 0, 0, 0); \
        { v2u w; w.x = pk2(vn[0], vn[1]); w.y = pk2(vn[2], vn[3]); *(LAS v2u*)(VNT + c * VNP + 16 * wi + 4 * g) = w; } \
        LDS_BAR(); \
        const bf16x8_t v0 = *(const LAS bf16x8_t*)(VNT + c * VNP + 8 * g), v1 = *(const LAS bf16x8_t*)(VNT + c * VNP + 32 + 8 * g); \
        pg8::f32x4 o = {0.f, 0.f, 0.f, 0.f}; \
        _Pragma("unroll") for (int ks = 0; ks < 4; ++ks) o = __builtin_amdgcn_mfma_f32_16x16x32_bf16(F.qg[ks], sf[ks], o, 0, 0, 0); \
        o = __builtin_amdgcn_mfma_f32_16x16x32_bf16(F.at[0], v0, o, 0, 0, 0); o = __builtin_amdgcn_mfma_f32_16x16x32_bf16(F.at[1], v1, o, 0, 0, 0); \
        { const size_t tb = (size_t)(n_) * 64 + 16 * wi + 4 * g; _Pragma("unroll") for (int r = 0; r < 4; ++r) GO[(tb + r) * BW + h * 128 + 16 * sl + c] = o[r]; } \
        _Pragma("unroll") for (int mt = 0; mt < 2; ++mt) { Sacc[mt] = Sacc[mt] * F.dl; \
            Sacc[mt] = __builtin_amdgcn_mfma_f32_16x16x32_bf16(F.kt[mt][0], v0, Sacc[mt], 0, 0, 0); Sacc[mt] = __builtin_amdgcn_mfma_f32_16x16x32_bf16(F.kt[mt][1], v1, Sacc[mt], 0, 0, 0); \
            v2u w; w.x = pk2(Sacc[mt][0], Sacc[mt][1]); w.y = pk2(Sacc[mt][2], Sacc[mt][3]); *(LAS v2u*)(ST + (cur ^ 1) * 16 * STP + c * STP + 16 * (2 * wi + mt) + 4 * g) = w; } \
        LDS_BAR(); } while (0)
    for (int n = 0; n < T / 64; n += 2) {
        gdn_load(F1, p, (n + 1) * 4 + h, off128, off64, offk, offu);
        GDN_STEP(F0, n);
        gdn_load(F0, p, ((n + 2 < T / 64) ? n + 2 : n) * 4 + h, off128, off64, offk, offu);
        GDN_STEP(F1, n + 1);
    }
#undef GDN_STEP
}

constexpr int SEQ_UOFF = 132096;
constexpr int GI_NW = 0, GI_QG = 8704, GI_AT = 17408, GI_KT = 22016, GI_SZ = 31232;
struct GdnStage { v4u r[7]; float u[4]; float dl; };
__device__ __forceinline__ void gdn_stage_load(GdnStage& Sg, const Params& p, int item, int tid, int offu) {
    const bf16* GNW = (const bf16*)(p.ws + WS_GNW) + (size_t)item * 8192; const bf16* GQG = (const bf16*)(p.ws + WS_GQG) + (size_t)item * 8192;
    const bf16* GAT = (const bf16*)(p.ws + WS_GAT) + (size_t)item * 4096; const bf16* GKT = (const bf16*)(p.ws + WS_GKT) + (size_t)item * 8192; const float* GU = (const float*)(p.ws + WS_GU) + (size_t)item * 8192;
    Sg.r[0] = *(const v4u*)(GNW + 8 * tid); Sg.r[1] = *(const v4u*)(GNW + 8 * (tid + 512)); Sg.r[2] = *(const v4u*)(GQG + 8 * tid); Sg.r[3] = *(const v4u*)(GQG + 8 * (tid + 512));
    Sg.r[4] = *(const v4u*)(GAT + 8 * tid); Sg.r[5] = *(const v4u*)(GKT + 8 * tid); Sg.r[6] = *(const v4u*)(GKT + 8 * (tid + 512));
#pragma unroll
    for (int r = 0; r < 4; ++r) Sg.u[r] = GU[offu + r * 128];
    Sg.dl = ((const float*)(p.ws + WS_GDL))[item];
}
__device__ __forceinline__ void gdn_stage_write(const GdnStage& Sg, LAS unsigned short* img, int tid) {
    { const int p0 = tid, p1 = tid + 512;
      *(LAS v4u*)(img + GI_NW + (p0 >> 4) * 136 + 8 * (p0 & 15)) = Sg.r[0]; *(LAS v4u*)(img + GI_NW + (p1 >> 4) * 136 + 8 * (p1 & 15)) = Sg.r[1];
      *(LAS v4u*)(img + GI_QG + (p0 >> 4) * 136 + 8 * (p0 & 15)) = Sg.r[2]; *(LAS v4u*)(img + GI_QG + (p1 >> 4) * 136 + 8 * (p1 & 15)) = Sg.r[3];
      *(LAS v4u*)(img + GI_AT + (p0 >> 3) * 72 + 8 * (p0 & 7)) = Sg.r[4];
      *(LAS v4u*)(img + GI_KT + (p0 >> 3) * 72 + 8 * (p0 & 7)) = Sg.r[5]; *(LAS v4u*)(img + GI_KT + (p1 >> 3) * 72 + 8 * (p1 & 7)) = Sg.r[6]; }
}
__device__ __forceinline__ void gdn_seq2(const Params& p, LAS unsigned char* lds, int wgi, int tid, int wave, int lane) {
    const int h = wgi >> 2, sl = 2 * (wgi & 3) + (wave >> 2), wi = wave & 3, g = lane >> 4, c = lane & 15;
    LAS unsigned short* IMG = (LAS unsigned short*)lds;
    LAS unsigned short* ST = (LAS unsigned short*)(lds + SEQ_UOFF + (wave >> 2) * 12288);
    LAS unsigned short* VNT = ST + 2 * 16 * STP;
    float* GO = (float*)(p.ws + WS_GO);
    const int offu = (16 * wi + 4 * g) * 128 + 16 * sl + c;
#pragma unroll
    for (int mt = 0; mt < 2; ++mt) *(LAS v2u*)(ST + c * STP + 16 * (2 * wi + mt) + 4 * g) = (v2u){0u, 0u};
    pg8::f32x4 Sacc[2] = {{0.f, 0.f, 0.f, 0.f}, {0.f, 0.f, 0.f, 0.f}};
    GdnStage A, B;
    gdn_stage_load(A, p, h, tid, offu); gdn_stage_write(A, IMG, tid);
    gdn_stage_load(B, p, 4 + h, tid, offu);
    LDS_BAR();
    constexpr int NCH = T / 64;
#define GDN_STEP2(X, Y, n_) do { const int cur = (n_) & 1; const LAS unsigned short* im = IMG + cur * GI_SZ; bf16x8_t sf[4]; \
        _Pragma("unroll") for (int ks = 0; ks < 4; ++ks) sf[ks] = *(const LAS bf16x8_t*)(ST + cur * 16 * STP + c * STP + 32 * ks + 8 * g); \
        pg8::f32x4 vn = {X.u[0], X.u[1], X.u[2], X.u[3]}; const float dl = X.dl; \
        _Pragma("unroll") for (int ks = 0; ks < 4; ++ks) vn = __builtin_amdgcn_mfma_f32_16x16x32_bf16(*(const LAS bf16x8_t*)(im + GI_NW + (16 * wi + c) * 136 + 32 * ks + 8 * g), sf[ks], vn, 0, 0, 0); \
        { v2u w; w.x = pk2(vn[0], vn[1]); w.y = pk2(vn[2], vn[3]); *(LAS v2u*)(VNT + c * VNP + 16 * wi + 4 * g) = w; } \
        pg8::f32x4 o = {0.f, 0.f, 0.f, 0.f}; \
        _Pragma("unroll") for (int ks = 0; ks < 4; ++ks) o = __builtin_amdgcn_mfma_f32_16x16x32_bf16(*(const LAS bf16x8_t*)(im + GI_QG + (16 * wi + c) * 136 + 32 * ks + 8 * g), sf[ks], o, 0, 0, 0); \
        LDS_BAR(); \
        gdn_stage_load(X, p, (((n_) + 2 < NCH) ? (n_) + 2 : (n_)) * 4 + h, tid, offu); \
        const bf16x8_t v0 = *(const LAS bf16x8_t*)(VNT + c * VNP + 8 * g), v1 = *(const LAS bf16x8_t*)(VNT + c * VNP + 32 + 8 * g); \
        o = __builtin_amdgcn_mfma_f32_16x16x32_bf16(*(const LAS bf16x8_t*)(im + GI_AT + (16 * wi + c) * 72 + 8 * g), v0, o, 0, 0, 0); \
        o = __builtin_amdgcn_mfma_f32_16x16x32_bf16(*(const LAS bf16x8_t*)(im + GI_AT + (16 * wi + c) * 72 + 32 + 8 * g), v1, o, 0, 0, 0); \
        { const size_t tb = (size_t)(n_) * 64 + 16 * wi + 4 * g; _Pragma("unroll") for (int r = 0; r < 4; ++r) GO[(tb + r) * BW + h * 128 + 16 * sl + c] = o[r]; } \
        _Pragma("unroll") for (int mt = 0; mt < 2; ++mt) { Sacc[mt] = Sacc[mt] * dl; \
            Sacc[mt] = __builtin_amdgcn_mfma_f32_16x16x32_bf16(*(const LAS bf16x8_t*)(im + GI_KT + (16 * (2 * wi + mt) + c) * 72 + 8 * g), v0, Sacc[mt], 0, 0, 0); \
            Sacc[mt] = __builtin_amdgcn_mfma_f32_16x16x32_bf16(*(const LAS bf16x8_t*)(im + GI_KT + (16 * (2 * wi + mt) + c) * 72 + 32 + 8 * g), v1, Sacc[mt], 0, 0, 0); \
            v2u w; w.x = pk2(Sacc[mt][0], Sacc[mt][1]); w.y = pk2(Sacc[mt][2], Sacc[mt][3]); *(LAS v2u*)(ST + (cur ^ 1) * 16 * STP + c * STP + 16 * (2 * wi + mt) + 4 * g) = w; } \
        gdn_stage_write(Y, IMG + (cur ^ 1) * GI_SZ, tid); \
        LDS_BAR(); } while (0)
    for (int n = 0; n < NCH; n += 2) { GDN_STEP2(A, B, n); GDN_STEP2(B, A, n + 1); }
#undef GDN_STEP2
}
constexpr int MI_Q = 0, MI_S = 4608, MI_K = 9216, MI_SZ = 13824;
struct MlStage { v4u r[3]; bf16x8_t vt[2]; float fl; };
__device__ __forceinline__ void ml_stage_load(MlStage& Sg, const Params& p, int item, int tid, int offV) {
    const bf16* MQ = (const bf16*)(p.ws + WS_MQ) + (size_t)item * 4096; const bf16* MS = (const bf16*)(p.ws + WS_MS) + (size_t)item * 4096; const bf16* MK = (const bf16*)(p.ws + WS_MK) + (size_t)item * 4096;
    const bf16* MV = (const bf16*)(p.ws + WS_MV) + (size_t)item * 9216;
    Sg.r[0] = *(const v4u*)(MQ + 8 * tid); Sg.r[1] = *(const v4u*)(MS + 8 * tid); Sg.r[2] = *(const v4u*)(MK + 8 * tid);
    Sg.vt[0] = *(const bf16x8_t*)(MV + offV); Sg.vt[1] = *(const bf16x8_t*)(MV + offV + 32);
    Sg.fl = ((const float*)(p.ws + WS_MFL))[item];
}
__device__ __forceinline__ void ml_stage_write(const MlStage& Sg, LAS unsigned short* img, int tid) {
    const int o = (tid >> 3) * 72 + 8 * (tid & 7);
    *(LAS v4u*)(img + MI_Q + o) = Sg.r[0]; *(LAS v4u*)(img + MI_S + o) = Sg.r[1]; *(LAS v4u*)(img + MI_K + o) = Sg.r[2];
}
__device__ __forceinline__ void ml_seq2(const Params& p, LAS unsigned char* lds, int wgi, int tid, int wave, int lane) {
    const int h = wgi / 5, sl0 = 2 * (wgi % 5) + (wave >> 2), wi = wave & 3, g = lane >> 4, c = lane & 15;
    const bool real = sl0 < 9; const int sl = real ? sl0 : 8;
    LAS unsigned short* IMG = (LAS unsigned short*)lds;
    LAS unsigned short* CT = (LAS unsigned short*)(lds + SEQ_UOFF + (wave >> 2) * 8192);
    float* HO = (float*)(p.ws + WS_HO); float* HDEN = (float*)(p.ws + WS_HDEN);
    const int offV = (16 * sl + c) * 64 + 8 * g;
    *(LAS v2u*)(CT + c * 72 + 16 * wi + 4 * g) = (v2u){0u, 0u};
    pg8::f32x4 Cacc = {0.f, 0.f, 0.f, 0.f};
    MlStage A, B;
    ml_stage_load(A, p, h, tid, offV); ml_stage_write(A, IMG, tid);
    ml_stage_load(B, p, 4 + h, tid, offV);
    LDS_BAR();
    constexpr int NCH = T / 64;
#define ML_STEP2(X, Y, n_) do { const int cur = (n_) & 1; const LAS unsigned short* im = IMG + cur * MI_SZ; const int ro = (16 * wi + c) * 72 + 8 * g; \
        const bf16x8_t c0 = *(const LAS bf16x8_t*)(CT + cur * 16 * 72 + c * 72 + 8 * g), c1 = *(const LAS bf16x8_t*)(CT + cur * 16 * 72 + c * 72 + 32 + 8 * g); \
        const bf16x8_t vt0 = X.vt[0], vt1 = X.vt[1]; const float fl = X.fl; \
        pg8::f32x4 num = {0.f, 0.f, 0.f, 0.f}; \
        num = __builtin_amdgcn_mfma_f32_16x16x32_bf16(*(const LAS bf16x8_t*)(im + MI_Q + ro), c0, num, 0, 0, 0); num = __builtin_amdgcn_mfma_f32_16x16x32_bf16(*(const LAS bf16x8_t*)(im + MI_Q + ro + 32), c1, num, 0, 0, 0); \
        num = __builtin_amdgcn_mfma_f32_16x16x32_bf16(*(const LAS bf16x8_t*)(im + MI_S + ro), vt0, num, 0, 0, 0); num = __builtin_amdgcn_mfma_f32_16x16x32_bf16(*(const LAS bf16x8_t*)(im + MI_S + ro + 32), vt1, num, 0, 0, 0); \
        Cacc = Cacc * fl; \
        Cacc = __builtin_amdgcn_mfma_f32_16x16x32_bf16(*(const LAS bf16x8_t*)(im + MI_K + ro), vt0, Cacc, 0, 0, 0); Cacc = __builtin_amdgcn_mfma_f32_16x16x32_bf16(*(const LAS bf16x8_t*)(im + MI_K + ro + 32), vt1, Cacc, 0, 0, 0); \
        ml_stage_load(X, p, (((n_) + 2 < NCH) ? (n_) + 2 : (n_)) * 4 + h, tid, offV); \
        { v2u w; w.x = pk2(Cacc[0], Cacc[1]); w.y = pk2(Cacc[2], Cacc[3]); *(LAS v2u*)(CT + (cur ^ 1) * 16 * 72 + c * 72 + 16 * wi + 4 * g) = w; } \
        { const size_t tb = (size_t)(n_) * 64 + 16 * wi + 4 * g; \
          if (sl < 8) { _Pragma("unroll") for (int r = 0; r < 4; ++r) HO[(tb + r) * BW + h * 128 + 16 * sl + c] = num[r]; } \
          else if (c == 0 && real) { _Pragma("unroll") for (int r = 0; r < 4; ++r) HDEN[(tb + r) * 4 + h] = num[r]; } } \
        ml_stage_write(Y, IMG + (cur ^ 1) * MI_SZ, tid); \
        LDS_BAR(); } while (0)
    for (int n = 0; n < NCH; n += 2) { ML_STEP2(A, B, n); ML_STEP2(B, A, n + 1); }
#undef ML_STEP2
}

__device__ __forceinline__ void mixer_gmlp_item(const Params& p, int l, LAS unsigned char* lds, int item, int tid, int wave, int lane) {
    const int chunk = item >> 1, hf = item & 1; const size_t tok0 = (size_t)chunk * 128;
    const bf16* Z = (const bf16*)(p.ws + WS_Z);
    const float* ng = p.in[I_GMNG] + l * BW; const float* nb = p.in[I_GMNB] + l * BW;
    LAS unsigned short* vT = (LAS unsigned short*)lds;
    {   v4u raw[16];
#pragma unroll
        for (int r = 0; r < 16; ++r) raw[r] = *(const v4u*)(Z + (tok0 + wave * 16 + r) * ZC + ZC_GMV + 8 * lane);
        float gn[8], gb[8];
#pragma unroll
        for (int i = 0; i < 8; ++i) { gn[i] = ng[8 * lane + i]; gb[i] = nb[8 * lane + i]; }
#pragma unroll
        for (int r = 0; r < 16; ++r) { const int tk = wave * 16 + r; float x[8]; unpack8(raw[r], x); float s = 0.f;
#pragma unroll
            for (int i = 0; i < 8; ++i) { x[i] = gelu_tanh(x[i]); s += x[i]; }
            const float mean = wave_sum(s) * (1.f / 512.f); float ss = 0.f;
#pragma unroll
            for (int i = 0; i < 8; ++i) { x[i] -= mean; ss += x[i] * x[i]; }
            const float rstd = rsqrtf(wave_sum(ss) * (1.f / 512.f) + LN_EPS);
            if ((lane >> 5) == hf) { const int cl = ((lane >> 4) & 1) * 128 * 136 + 8 * (lane & 15) * 136;
#pragma unroll
                for (int i = 0; i < 8; ++i) vT[cl + i * 136 + tk] = (unsigned short)f2bf(x[i] * rstd * gn[i] + gb[i]); } } }
    __syncthreads();
#pragma unroll 1
    for (int gl = 0; gl < 2; ++gl) { const int g = 2 * hf + gl; const LAS unsigned short* vg = vT + gl * 128 * 136;
        const float* wsp = p.in[I_GMWS] + ((size_t)(l * 4 + g) * 128) * 128; const float* bsp = p.in[I_GMBS] + (l * 4 + g) * 128;
        const int c16 = lane & 15, g4 = lane >> 4, t = 16 * wave + c16, nks = ((16 * wave + 15) >> 5) + 1;
        bf16x8_t wf[4];
#pragma unroll
        for (int ks = 0; ks < 4; ++ks) { wf[ks] = (bf16x8_t){0, 0, 0, 0, 0, 0, 0, 0};
            if (ks < nks) { const float* wp = wsp + (size_t)t * 128 + 32 * ks + 8 * g4; const v4f a = *(const v4f*)wp, b = *(const v4f*)(wp + 4); const int s0 = 32 * ks + 8 * g4;
                const v4u w = (v4u){pk2(s0 <= t ? a.x : 0.f, s0 + 1 <= t ? a.y : 0.f), pk2(s0 + 2 <= t ? a.z : 0.f, s0 + 3 <= t ? a.w : 0.f), pk2(s0 + 4 <= t ? b.x : 0.f, s0 + 5 <= t ? b.y : 0.f), pk2(s0 + 6 <= t ? b.z : 0.f, s0 + 7 <= t ? b.w : 0.f)};
                wf[ks] = __builtin_bit_cast(bf16x8_t, w); } }
        pg8::f32x4 acc[8];
#pragma unroll
        for (int ct = 0; ct < 8; ++ct) acc[ct] = (pg8::f32x4){0.f, 0.f, 0.f, 0.f};
#pragma unroll
        for (int ks = 0; ks < 4; ++ks) { if (ks < nks) {
#pragma unroll
            for (int ct = 0; ct < 8; ++ct) acc[ct] = __builtin_amdgcn_mfma_f32_16x16x32_bf16(*(const LAS bf16x8_t*)(vg + (16 * ct + c16) * 136 + 32 * ks + 8 * g4), wf[ks], acc[ct], 0, 0, 0); } }
        const float bias = bsp[t]; v2u ur[8];
#pragma unroll
        for (int ct = 0; ct < 8; ++ct) ur[ct] = *(const v2u*)(Z + (tok0 + t) * ZC + ZC_GMU + g * 128 + 16 * ct + 4 * g4);
#pragma unroll
        for (int ct = 0; ct < 8; ++ct) { const float u0 = bflo(ur[ct].x), u1 = bfhi(ur[ct].x), u2 = bflo(ur[ct].y), u3 = bfhi(ur[ct].y);
            const float o0 = gelu_tanh(u0) * (acc[ct][0] + bias), o1 = gelu_tanh(u1) * (acc[ct][1] + bias), o2 = gelu_tanh(u2) * (acc[ct][2] + bias), o3 = gelu_tanh(u3) * (acc[ct][3] + bias);
#if MERGE_FP8
            *(unsigned*)((unsigned char*)(p.ws + WS_BR) + (tok0 + t) * BRW + 1 * BW + g * 128 + 16 * ct + 4 * g4) = pk4_f8(o0, o1, o2, o3, BRSC); }
#else
            *(v2u*)((bf16*)(p.ws + WS_BR) + (tok0 + t) * BRW + 1 * BW + g * 128 + 16 * ct + 4 * g4) = (v2u){pk2(o0, o1), pk2(o2, o3)}; }
#endif
    }
    __syncthreads();
}

__device__ __forceinline__ void vt_item(const Params& p, LAS unsigned char* lds, int item, int tid) {
    const int h = item & 3, n = item >> 2; const size_t t0 = (size_t)n * 64;
    const bf16* Z = (const bf16*)(p.ws + WS_Z); bf16* VT = (bf16*)(p.ws + WS_VT);
    LAS unsigned short* vs = (LAS unsigned short*)lds;
#pragma unroll
    for (int r = 0; r < 2; ++r) { const int idx = tid + 512 * r, tk = idx >> 4, c8 = idx & 15;
        *(LAS v4u*)(vs + tk * 136 + 8 * c8) = *(const v4u*)(Z + (t0 + tk) * ZC + ZC_SBV + h * 128 + 8 * c8); }
    __syncthreads();
    { const int d = tid >> 2, jq = tid & 3; unsigned w[8];
#pragma unroll
      for (int x = 0; x < 8; ++x) w[x] = (unsigned)vs[(16 * jq + 2 * x) * 136 + d] | ((unsigned)vs[(16 * jq + 2 * x + 1) * 136 + d] << 16);
      bf16* dst = VT + ((size_t)h * 128 + d) * T + t0 + 16 * jq;
      *(v4u*)dst = (v4u){w[0], w[1], w[2], w[3]}; *(v4u*)(dst + 8) = (v4u){w[4], w[5], w[6], w[7]}; }
    __syncthreads();
}
constexpr int KTP = 136, VTP = 72;
__device__ __forceinline__ void sb_unit(const Params& p, LAS unsigned char* lds, int unit, int tid, int wave, int lane) {
    const int h = unit >> 6, q0 = (unit & 63) * 128, g = lane >> 4, c = lane & 15; const int qrow = q0 + 16 * wave + c;
    const bf16* Z = (const bf16*)(p.ws + WS_Z); const bf16* VT = (const bf16*)(p.ws + WS_VT) + (size_t)h * 128 * T; bf16* BR0 = (bf16*)(p.ws + WS_BR);
    LAS unsigned short* Kt = (LAS unsigned short*)lds;
    LAS unsigned short* Vt = Kt + 2 * 64 * KTP;
    LAS int* flags = (LAS int*)(Vt + 2 * 128 * VTP);
    bf16x8_t qf[4];
#pragma unroll
    for (int ks = 0; ks < 4; ++ks) qf[ks] = *(const bf16x8_t*)(Z + (size_t)qrow * ZC + ZC_SBQ + h * 128 + 32 * ks + 8 * g);
    pg8::f32x4 acc[8];
#pragma unroll
    for (int dt = 0; dt < 8; ++dt) acc[dt] = (pg8::f32x4){0.f, 0.f, 0.f, 0.f};
    float racc = 0.f;
    v4u kr[2], vr[2];
    const int jt = (q0 >> 6) + 1;
#define SB_GLOAD(j_) do { _Pragma("unroll") for (int r = 0; r < 2; ++r) { const int idx = tid + 512 * r; \
        kr[r] = *(const v4u*)(Z + (size_t)(64 * (j_) + (idx >> 4)) * ZC + ZC_SBK + h * 128 + 8 * (idx & 15)); \
        vr[r] = *(const v4u*)(VT + (size_t)(idx >> 3) * T + 64 * (j_) + 8 * (idx & 7)); } } while (0)
#define SB_LWRITE(b_) do { _Pragma("unroll") for (int r = 0; r < 2; ++r) { const int idx = tid + 512 * r; \
        *(LAS v4u*)(Kt + (b_) * 64 * KTP + (idx >> 4) * KTP + 8 * (idx & 15)) = kr[r]; *(LAS v4u*)(Vt + (b_) * 128 * VTP + (idx >> 3) * VTP + 8 * (idx & 7)) = vr[r]; } } while (0)
    LDS_BAR();
    SB_GLOAD(jt); SB_LWRITE(0);
    LDS_BAR();
    for (int j = jt, it = 0; j >= 0; --j, ++it) {
        const int cur = it & 1;
        SB_GLOAD(j > 0 ? j - 1 : 0);
        const bool wdone = __all(racc > 104.f);
        if (64 * j < q0 + 16 * wave + 15 && !wdone) {
            const LAS unsigned short* Kc = Kt + cur * 64 * KTP; const LAS unsigned short* Vc = Vt + cur * 128 * VTP;
            pg8::f32x4 z[4];
#pragma unroll
            for (int s = 0; s < 4; ++s) { z[s] = (pg8::f32x4){0.f, 0.f, 0.f, 0.f};
#pragma unroll
                for (int ks = 0; ks < 4; ++ks) z[s] = __builtin_amdgcn_mfma_f32_16x16x32_bf16(*(const LAS bf16x8_t*)(Kc + (16 * s + c) * KTP + 32 * ks + 8 * g), qf[ks], z[s], 0, 0, 0); }
            float sp[4][4], t[4], xs[4]; bool mk[4][4];
#pragma unroll
            for (int s = 0; s < 4; ++s) { t[s] = 0.f;
#pragma unroll
                for (int r = 0; r < 4; ++r) { const int key = 64 * j + 16 * s + 4 * g + r; mk[s][r] = key < qrow; const float zz = z[s][r] * 0.08838834764831845f; z[s][r] = zz;
                    sp[s][r] = mk[s][r] ? softplusf_(zz) : 0.f; t[s] += sp[s][r]; } }
            float grand = 0.f, higher[4];
#pragma unroll
            for (int s = 3; s >= 0; --s) { float x = t[s]; float y = __shfl(x, lane + 16); x += (g < 3) ? y : 0.f; y = __shfl(x, lane + 32); x += (g < 2) ? y : 0.f;
                xs[s] = x - t[s];
                const float tot = __shfl(x, c); higher[s] = grand; grand += tot; }
            bf16x8_t pf[2];
#pragma unroll
            for (int s = 0; s < 4; ++s) { float a[4]; float e = 0.f;
#pragma unroll
                for (int r = 3; r >= 0; --r) { const float la = z[s][r] - sp[s][r] - (racc + higher[s] + xs[s] + e); a[r] = mk[s][r] ? __expf(la) : 0.f; e += sp[s][r]; }
                const unsigned w0 = pk2(a[0], a[1]), w1 = pk2(a[2], a[3]);
                if ((s & 1) == 0) { pf[s >> 1][0] = (short)(w0 & 0xffff); pf[s >> 1][1] = (short)(w0 >> 16); pf[s >> 1][2] = (short)(w1 & 0xffff); pf[s >> 1][3] = (short)(w1 >> 16); }
                else              { pf[s >> 1][4] = (short)(w0 & 0xffff); pf[s >> 1][5] = (short)(w0 >> 16); pf[s >> 1][6] = (short)(w1 & 0xffff); pf[s >> 1][7] = (short)(w1 >> 16); } }
            racc += grand;
#pragma unroll
            for (int dt = 0; dt < 8; ++dt)
#pragma unroll
                for (int k2 = 0; k2 < 2; ++k2) { const v2u lo = *(const LAS v2u*)(Vc + (16 * dt + c) * VTP + 32 * k2 + 4 * g), hi = *(const LAS v2u*)(Vc + (16 * dt + c) * VTP + 32 * k2 + 16 + 4 * g);
                    const v4u vv = (v4u){lo.x, lo.y, hi.x, hi.y};
                    acc[dt] = __builtin_amdgcn_mfma_f32_16x16x32_bf16(__builtin_bit_cast(bf16x8_t, vv), pf[k2], acc[dt], 0, 0, 0); }
        }
        const bool wd2 = __all(racc > 104.f);
        if (lane == 0) flags[cur * 8 + wave] = wd2 ? 1 : 0;
        SB_LWRITE(cur ^ 1);
        LDS_BAR();
        int alld = 1;
#pragma unroll
        for (int w = 0; w < 8; ++w) alld &= flags[cur * 8 + w];
        if (alld) break;
    }
#undef SB_GLOAD
#undef SB_LWRITE
#pragma unroll
#if MERGE_FP8
    for (int dt = 0; dt < 8; ++dt) *(unsigned*)((unsigned char*)BR0 + (size_t)qrow * BRW + h * 128 + 16 * dt + 4 * g) = pk4_f8(acc[dt][0], acc[dt][1], acc[dt][2], acc[dt][3], BRSC);
#else
    for (int dt = 0; dt < 8; ++dt) { v2u w; w.x = pk2(acc[dt][0], acc[dt][1]); w.y = pk2(acc[dt][2], acc[dt][3]); *(v2u*)(BR0 + (size_t)qrow * BRW + h * 128 + 16 * dt + 4 * g) = w; }
#endif
}

struct GateOrder {
    pg8::StaticOrder s; int pn0;
    __device__ __forceinline__ bool next(int i, pg8::Unit& u) const { if (!s.next(i, u)) return false; u.pn += pn0; return true; }
    __device__ __forceinline__ void a_ready(const pg8::Unit&) const {}
    __device__ __forceinline__ void done(const pg8::Unit&) const {}
};
constexpr int GATE_PN0 = ZC_GATE / 256, GATE_WGS = 128;
__device__ __forceinline__ void phase_mixers(const Params& p, int l, LAS unsigned char* lds, int wg, int G, int tid, int wave, int lane, const XcdBarrier& bar) {
#if defined(PROBE_SPLIT)
    if (wg < 16) gdn_seq2(p, lds, wg, tid, wave, lane); else if (wg < 36) ml_seq2(p, lds, wg - 16, tid, wave, lane);
    xcd_barrier(bar);
    const int w2 = wg, G2 = G;
#else
    if (wg < 16) { gdn_seq2(p, lds, wg, tid, wave, lane); return; }
    if (wg < 36) { ml_seq2(p, lds, wg - 16, tid, wave, lane); return; }
    const int w2 = wg - 36, G2 = G - 36;
#endif
    if (GATE_SPLIT && G == 256) {
        if (w2 < GATE_WGS) {
            for (int it = w2; it < 128; it += GATE_WGS) mixer_gmlp_item(p, l, lds, it, tid, wave, lane);
            for (int it = w2; it < 256; it += GATE_WGS) sb_unit(p, lds, it, tid, wave, lane);
            __syncthreads();
            pg8::Gemm g{(const bf16*)(p.ws + WS_XB), (const bf16*)(p.ws + WS_WIN), T, ZC, D / 2, D / 2, D / 2}; GateOrder S; S.s.init(T, ZC - ZC_GATE, GATE_WGS, w2); S.pn0 = GATE_PN0;
#if GATE_FP8
            EpiGate8 E{p.ws + WS_MTMP, 1.f / 64.f};
            pg8::gemm_phase<EpiGate8, GateOrder, true, true, true>(lds, g, S, E);
#else
            pg8::EpiBf16<0> E{(bf16*)(p.ws + WS_Z), ZC, nullptr, 0, 0, 1.f / 64.f};
            pg8::gemm_phase<pg8::EpiBf16<0>, GateOrder, true, true, true>(lds, g, S, E);
#endif
        } else { const int w3 = w2 - GATE_WGS, G3 = G2 - GATE_WGS; __syncthreads();
            phase_convert<1>(p, l, lds, w3 * 8 + wave, G3 * 8, wave, lane); }
        return; }
    for (int it = w2; it < 128; it += G2) mixer_gmlp_item(p, l, lds, it, tid, wave, lane);
    for (int it = w2; it < 256; it += G2) sb_unit(p, lds, it, tid, wave, lane);
#if !defined(PROBE_CONV0)
    __syncthreads();
    {
        constexpr int NIT1 = (NEX * 2 * (D / 64) * (ED / 32)) + (NEX * (ED / 64) * (D / 32));
        const int nheavy = (G2 < 256 && 2 * G2 >= 256) ? 256 - G2 : 0, per_wave = NIT1 / (G2 * 8);
        const int NA = (nheavy > 0 && per_wave > 2 * CONV_SKIP) ? (per_wave - CONV_SKIP) * (G2 * 8) : NIT1;
        phase_convert<1>(p, l, lds, w2 * 8 + wave, G2 * 8, wave, lane, false, 0, NA);
        if (NA < NIT1 && w2 >= nheavy) phase_convert<1>(p, l, lds, (w2 - nheavy) * 8 + wave, (G2 - nheavy) * 8, wave, lane, false, NA, NIT1); }
#endif
}

__device__ __forceinline__ void phase_post(const Params& p, int l, int gw, int NGW, int lane) {
    const bf16* Z = (const bf16*)(p.ws + WS_Z); const float* GO = (const float*)(p.ws + WS_GO); const float* HO = (const float*)(p.ws + WS_HO); const float* HDEN = (const float*)(p.ws + WS_HDEN);
    bf16* BR2 = (bf16*)(p.ws + WS_BR) + 2 * BW; bf16* BR3 = (bf16*)(p.ws + WS_BR) + 3 * BW;
    const float* gng = p.in[I_GDNNG] + l * 128; const float* mng = p.in[I_MLNG] + l * BW;
    for (int t = gw; t < T; t += NGW) {
        {   const v4f a0 = *(const v4f*)(GO + (size_t)t * BW + 8 * lane), a1 = *(const v4f*)(GO + (size_t)t * BW + 8 * lane + 4); float o[8] = {a0.x, a0.y, a0.z, a0.w, a1.x, a1.y, a1.z, a1.w}; float ss = 0.f;
#pragma unroll
            for (int i = 0; i < 8; ++i) ss += o[i] * o[i];
            const float r = rsqrtf(sum16(ss) * (1.f / 128.f) + LN_EPS);
            const v4u graw = *(const v4u*)(Z + (size_t)t * ZC + ZC_GDNG + 8 * lane); float gt[8]; unpack8(graw, gt);
#pragma unroll
            for (int i = 0; i < 8; ++i) o[i] = o[i] * r * gng[(8 * lane + i) & 127] * siluf_(gt[i]);
#if MERGE_FP8
            *(v2u*)((unsigned char*)(p.ws + WS_BR) + (size_t)t * BRW + 2 * BW + 8 * lane) = (v2u){pk4_f8(o[0], o[1], o[2], o[3], BRSC), pk4_f8(o[4], o[5], o[6], o[7], BRSC)}; }
#else
            v4u w; w.x = pk2(o[0], o[1]); w.y = pk2(o[2], o[3]); w.z = pk2(o[4], o[5]); w.w = pk2(o[6], o[7]); *(v4u*)(BR2 + (size_t)t * BRW + 8 * lane) = w; }
#endif
        {   const v4f a0 = *(const v4f*)(HO + (size_t)t * BW + 8 * lane), a1 = *(const v4f*)(HO + (size_t)t * BW + 8 * lane + 4); float o[8] = {a0.x, a0.y, a0.z, a0.w, a1.x, a1.y, a1.z, a1.w}; float ss = 0.f;
            const float dn = __builtin_amdgcn_rcpf(fmaxf(fabsf(HDEN[(size_t)t * 4 + (lane >> 4)]), 1.f));
#pragma unroll
            for (int i = 0; i < 8; ++i) { o[i] *= dn; ss += o[i] * o[i]; }
            const float r = rsqrtf(sum16(ss) * (1.f / 128.f) + LN_EPS);
            const v4u graw = *(const v4u*)(Z + (size_t)t * ZC + ZC_MLO + 8 * lane); float gt[8]; unpack8(graw, gt);
#pragma unroll
            for (int i = 0; i < 8; ++i) o[i] = o[i] * r * mng[8 * lane + i] * sigmoidf_(gt[i]);
#if MERGE_FP8
            *(v2u*)((unsigned char*)(p.ws + WS_BR) + (size_t)t * BRW + 3 * BW + 8 * lane) = (v2u){pk4_f8(o[0], o[1], o[2], o[3], BRSC), pk4_f8(o[4], o[5], o[6], o[7], BRSC)}; }
#else
            v4u w; w.x = pk2(o[0], o[1]); w.y = pk2(o[2], o[3]); w.z = pk2(o[4], o[5]); w.w = pk2(o[6], o[7]); *(v4u*)(BR3 + (size_t)t * BRW + 8 * lane) = w; }
#endif
    }
}

__device__ __forceinline__ void ln_row(const float* yrow, const float* g, const float* b, int lane, v4f (&v)[8]) {
    const v4f* yr = (const v4f*)yrow + lane; float s = 0.f;
#pragma unroll
    for (int j = 0; j < 8; ++j) { v[j] = yr[64 * j]; s += (v[j].x + v[j].y) + (v[j].z + v[j].w); }
    const float mean = wave_sum(s) * (1.f / D); float s2 = 0.f;
#pragma unroll
    for (int j = 0; j < 8; ++j) { v[j] = v[j] - mean; s2 += (v[j].x * v[j].x + v[j].y * v[j].y) + (v[j].z * v[j].z + v[j].w * v[j].w); }
    const float rstd = rsqrtf(wave_sum(s2) * (1.f / D) + LN_EPS);
#pragma unroll
    for (int j = 0; j < 8; ++j) { const v4f gg = ((const v4f*)g)[lane + 64 * j], bb = ((const v4f*)b)[lane + 64 * j]; v[j] = v[j] * rstd * gg + bb; }
}
constexpr int RT_XP = 2052;
constexpr int RT_TAB = 131072 + 1024;
__device__ __forceinline__ void phase_ln1_router(const Params& p, int l, LAS unsigned char* lds, int wg, int G, int wave, int lane, int cnt_shift = 0) {
    const bf16* Y = (const bf16*)(p.ws + WS_Y); bf16* X1 = (bf16*)(p.ws + WS_X1); bf16* X1B = (bf16*)(p.ws + WS_X1B); int* LIST = (int*)(p.ws + WS_LIST); float* WL = (float*)(p.ws + WS_WL); unsigned* SLOT = (unsigned*)(p.ws + WS_SLOT);
    unsigned* cnt = (unsigned*)(p.ws + WS_CTL) + CW_CNT + l * 4096 + cnt_shift;
    const float* g1 = p.in[I_LN1G] + (size_t)l * D; const float* b1 = p.in[I_LN1B] + (size_t)l * D;
    const float* wr = p.in[I_WR] + (size_t)l * D * NE; const float rbias = p.in[I_RB][l * NE + lane];
    LAS float* xt = (LAS float*)lds;
    LAS float* part = (LAS float*)lds;
    LAS unsigned char* selm = lds + RT_TAB; LAS unsigned char* rkm = selm + 4096; LAS float* wtm = (LAS float*)(rkm + 4096); LAS unsigned* basem = (LAS unsigned*)(wtm + 4096);
    const int n_l = lane & 15, kq = lane >> 4;
    int gi = 0;
    for (int tg = wg; tg < T / 16; tg += G, ++gi) {
        {   v4f va[8], vb[8]; const size_t m0 = (size_t)tg * 16 + 2 * wave;
#pragma unroll
            for (int j = 0; j < 8; ++j) { va[j] = ld4_nt(Y, m0 * D + 4 * lane + 256 * j, true); vb[j] = ld4_nt(Y, (m0 + 1) * D + 4 * lane + 256 * j, true); }
            float sa = 0.f, sb = 0.f;
#pragma unroll
            for (int j = 0; j < 8; ++j) { sa += (va[j].x + va[j].y) + (va[j].z + va[j].w); sb += (vb[j].x + vb[j].y) + (vb[j].z + vb[j].w); }
            const float ma = wave_sum(sa) * (1.f / D), mb = wave_sum(sb) * (1.f / D); float qa = 0.f, qb = 0.f;
#pragma unroll
            for (int j = 0; j < 8; ++j) { va[j] = va[j] - ma; vb[j] = vb[j] - mb; qa += (va[j].x * va[j].x + va[j].y * va[j].y) + (va[j].z * va[j].z + va[j].w * va[j].w); qb += (vb[j].x * vb[j].x + vb[j].y * vb[j].y) + (vb[j].z * vb[j].z + vb[j].w * vb[j].w); }
            const float ra = rsqrtf(wave_sum(qa) * (1.f / D) + LN_EPS), rb = rsqrtf(wave_sum(qb) * (1.f / D) + LN_EPS);
#pragma unroll
            for (int j = 0; j < 8; ++j) { const v4f gg = ((const v4f*)g1)[lane + 64 * j], bb = ((const v4f*)b1)[lane + 64 * j]; va[j] = va[j] * ra * gg + bb; vb[j] = vb[j] * rb * gg + bb; }
#pragma unroll
            for (int rr = 0; rr < 2; ++rr) { const size_t m = m0 + rr; v2u* xo = (v2u*)(X1 + m * D) + lane;
#pragma unroll
                for (int j = 0; j < 8; ++j) { const v4f v = rr ? vb[j] : va[j]; xo[64 * j] = (v2u){pk2(v.x, v.y), pk2(v.z, v.w)};
#if MOE_UP_FP8
                    { unsigned w = 0; w = __builtin_amdgcn_cvt_pk_fp8_f32(v.x, v.y, w, false); w = __builtin_amdgcn_cvt_pk_fp8_f32(v.z, v.w, w, true); ((unsigned*)((unsigned char*)X1B + m * D))[lane + 64 * j] = w; }
#else
                    { v2u o; o.x = pk2(v.x, v.y); o.y = pk2(v.z, v.w); ((v2u*)(X1B + m * D))[lane + 64 * j] = o; }
#endif
                    *(LAS v4f*)(xt + (2 * wave + rr) * RT_XP + 4 * lane + 256 * j) = v; } } }
        __syncthreads();
        {   pg8::f32x4 acc[4];
#pragma unroll
            for (int i = 0; i < 4; ++i) acc[i] = (pg8::f32x4){0.f, 0.f, 0.f, 0.f};
            const float* wb = wr + (size_t)(256 * wave + 4 * kq) * NE + 4 * n_l;
            const LAS float* xa = xt + n_l * RT_XP + 256 * wave + 4 * kq;
            v4f bwa[16], bwb[16];
#define RT_LOADW(dst, sb_) do { _Pragma("unroll") for (int q = 0; q < 16; ++q) dst[q] = *(const v4f*)(wb + (size_t)(16 * (4 * (sb_) + (q >> 2)) + (q & 3)) * NE); } while (0)
#define RT_MMA(src, sb_) do { _Pragma("unroll") for (int sg = 0; sg < 4; ++sg) { const v4f a4 = *(const LAS v4f*)(xa + 16 * (4 * (sb_) + sg)); \
                _Pragma("unroll") for (int c = 0; c < 4; ++c) { const v4f b4 = src[sg * 4 + c]; const float a = c == 0 ? a4.x : c == 1 ? a4.y : c == 2 ? a4.z : a4.w; \
                    acc[0] = __builtin_amdgcn_mfma_f32_16x16x4f32(a, b4.x, acc[0], 0, 0, 0); acc[1] = __builtin_amdgcn_mfma_f32_16x16x4f32(a, b4.y, acc[1], 0, 0, 0); \
                    acc[2] = __builtin_amdgcn_mfma_f32_16x16x4f32(a, b4.z, acc[2], 0, 0, 0); acc[3] = __builtin_amdgcn_mfma_f32_16x16x4f32(a, b4.w, acc[3], 0, 0, 0); } } } while (0)
            RT_LOADW(bwa, 0);
#pragma unroll 1
            for (int h = 0; h < 2; ++h) {
                RT_LOADW(bwb, 1); RT_MMA(bwa, 0);
                if (h == 0) RT_LOADW(bwa, 2);
                RT_MMA(bwb, 1);
                wb += (size_t)128 * NE; xa += 128; asm volatile("" : "+v"(wb));
            }
#undef RT_LOADW
#undef RT_MMA
            __syncthreads();
#pragma unroll
            for (int j = 0; j < 4; ++j) *(LAS v4f*)(part + (wave * 16 + 4 * kq + j) * 64 + 4 * n_l) = (v4f){acc[0][j], acc[1][j], acc[2][j], acc[3][j]}; }
        __syncthreads();
#pragma unroll 1
        for (int rr = 0; rr < 2; ++rr) { const int lr = wave + 8 * rr; float logit = 0.f;
#pragma unroll
            for (int w = 0; w < 8; ++w) logit += part[(w * 16 + lr) * 64 + lane];
            const float s = sigmoid_div(logit), biased = s + rbias;
            const float m1 = max8(biased); const float li = (float)(lane & 7);
            const float first = min8(biased == m1 ? li : 8.f);
            const float m2 = max8(li == first ? -INFINITY : biased);
            const float gs = m1 + m2; const int myg = lane >> 3; int grank = 0;
#pragma unroll
            for (int g2 = 0; g2 < 8; ++g2) { const float o = __builtin_bit_cast(float, __builtin_amdgcn_readlane(__builtin_bit_cast(int, gs), g2 * 8)); grank += (o > gs || (o == gs && g2 < myg)) ? 1 : 0; }
            const float masked = grank < 4 ? biased : -INFINITY; int rank = 0;
#pragma unroll 8
            for (int e2 = 0; e2 < 64; ++e2) { const float o = __builtin_bit_cast(float, __builtin_amdgcn_readlane(__builtin_bit_cast(int, masked), e2)); rank += (o > masked || (o == masked && e2 < lane)) ? 1 : 0; }
            const float wsel = rank < 6 ? s : 0.f; const float tot = wave_sum(wsel);
            const int ri = gi * 16 + lr;
            selm[ri * 64 + lane] = (rank < 6) ? 1 : 0; rkm[ri * 64 + lane] = (unsigned char)rank; wtm[ri * 64 + lane] = wsel / tot * 2.5f; }
        __syncthreads();
    }
    const int nrows = gi * 16;
    if (wave == 0) { unsigned n = 0;
        for (int r = 0; r < nrows; ++r) n += selm[r * 64 + lane];
        unsigned base = 0; if (n && !(PROBE_NOATOM && cnt_shift)) base = __hip_atomic_fetch_add(cnt + 64 * lane, n, __ATOMIC_RELAXED, __HIP_MEMORY_SCOPE_AGENT);
        basem[lane] = base; }
    __syncthreads();
    for (int ri = wave; ri < nrows; ri += 8) { unsigned pos = basem[lane];
        for (int r = 0; r < ri; ++r) pos += selm[r * 64 + lane];
        if (selm[ri * 64 + lane]) { const size_t m = (size_t)(wg + (ri >> 4) * G) * 16 + (ri & 15); const int rk = rkm[ri * 64 + lane];
            LIST[lane * T + pos] = (int)m; WL[lane * T + pos] = wtm[ri * 64 + lane]; SLOT[m * 8 + rk] = ((unsigned)lane << 16) | pos; } }
    __syncthreads();
}
__device__ __forceinline__ void phase_combine_ln2(const Params& p, int l, void* dst, bool dbf, int gw, int NGW, int lane) {
    const bf16* X1 = (const bf16*)(p.ws + WS_X1); const bf16* YE = (const bf16*)(p.ws + WS_YEXP); const unsigned* SLOT = (const unsigned*)(p.ws + WS_SLOT);
    const unsigned* cnt = (const unsigned*)(p.ws + WS_CTL) + CW_CNT + l * 4096;
    const float* g2 = p.in[I_LN2G] + (size_t)l * D; const float* b2 = p.in[I_LN2B] + (size_t)l * D;
    const int tiles = ((int)cnt[64 * lane] + 255) >> 8; const float incl = wave_scan_incl((float)tiles);
    const int toff = (int)incl - tiles;
    const int tsh = __builtin_amdgcn_readlane((int)incl, 63);
    for (int m = gw; m < T; m += NGW) {
        v4f v[8];
#pragma unroll
        for (int j = 0; j < 8; ++j) v[j] = ld4_nt(X1, (size_t)m * D + 4 * lane + 256 * j, true) * ALPHA;
#pragma unroll
        for (int k = 0; k < 7; ++k) { size_t row;
            if (k == 0) row = (size_t)tsh * 256 + m;
            else { const unsigned s = __builtin_amdgcn_readfirstlane(SLOT[(size_t)m * 8 + (k - 1)]); const int e = (int)(s >> 16); row = (size_t)__builtin_amdgcn_readlane(toff, e) * 256 + (s & 0xffffu); }
#if YEXP_FP8
            const unsigned* yr = (const unsigned*)((const unsigned char*)YE + row * D) + lane;
#pragma unroll
            for (int j = 0; j < 8; ++j) { const unsigned y = __builtin_nontemporal_load(yr + 64 * j); const auto lo = __builtin_amdgcn_cvt_pk_f32_fp8(y, false), hi = __builtin_amdgcn_cvt_pk_f32_fp8(y, true);
                v[j].x += lo[0] * (1.f / YSC); v[j].y += lo[1] * (1.f / YSC); v[j].z += hi[0] * (1.f / YSC); v[j].w += hi[1] * (1.f / YSC); } }
#else
            const v2u* yr = (const v2u*)(YE + row * D) + lane;
#pragma unroll
            for (int j = 0; j < 8; ++j) { const v2u y = yr[64 * j]; v[j].x += bflo(y.x); v[j].y += bfhi(y.x); v[j].z += bflo(y.y); v[j].w += bfhi(y.y); } }
#endif
        float s = 0.f;
#pragma unroll
        for (int j = 0; j < 8; ++j) s += (v[j].x + v[j].y) + (v[j].z + v[j].w);
        const float mean = wave_sum(s) * (1.f / D); float s2 = 0.f;
#pragma unroll
        for (int j = 0; j < 8; ++j) { v[j] = v[j] - mean; s2 += (v[j].x * v[j].x + v[j].y * v[j].y) + (v[j].z * v[j].z + v[j].w * v[j].w); }
        const float rstd = rsqrtf(wave_sum(s2) * (1.f / D) + LN_EPS);
#pragma unroll
        for (int j = 0; j < 8; ++j) { const v4f gg = ((const v4f*)g2)[lane + 64 * j], bb = ((const v4f*)b2)[lane + 64 * j]; const v4f o = v[j] * rstd * gg + bb;
            if (dbf) ((v2u*)((bf16*)dst + (size_t)m * D))[lane + 64 * j] = (v2u){pk2(o.x, o.y), pk2(o.z, o.w)};
            else ((v4f*)((float*)dst + (size_t)m * D))[lane + 64 * j] = o; }
    }
}

constexpr int NPH = 11;
template <class S> struct DupOrder {
    S s; int n;
    __device__ __forceinline__ bool next(int i, Unit& u) const { return s.next(i >= n ? i - n : i, u); }
    __device__ __forceinline__ int row_token(int i, int r) const { return s.row_token(i >= n ? i - n : i, r); }
    __device__ __forceinline__ void a_ready(const Unit& u) const { s.a_ready(u); }
    __device__ __forceinline__ void done(const Unit& u) const { s.done(u); }
};
template <class S> __device__ __forceinline__ int count_units(const S& s) { Unit u; int n = 0; while (n < 64 && s.next(n, u)) ++n; return n; }
#define ORDER_T(k, T) typename std::conditional<PROBE_DUP == (k), DupOrder<T>, T>::type
template <class S> __device__ __forceinline__ DupOrder<S> make_order(const S& s, std::true_type) { DupOrder<S> d{s, count_units(s)}; d.n = count_units(s); return d; }
template <class S> __device__ __forceinline__ S make_order(const S& s, std::false_type) { return s; }
#define MAKE_ORDER(k, s) make_order(s, std::integral_constant<bool, PROBE_DUP == (k)>())
template <int l>
__device__ __forceinline__ void run_layer(const Params& p, LAS unsigned char* lds, const XcdBarrier& bar, int tid, int lane, int wave, int G, int wg, int gw, int NGW) {
    unsigned char* ws = p.ws;
    {
        const void* xin = (l == 0) ? (const void*)p.in[I_X] : (const void*)(ws + WS_XCUR);
        void* xout = (l == NL - 1) ? (void*)p.out : (void*)(ws + WS_XCUR);
#ifndef PROBE_DUP
#define PROBE_DUP (-1)
#endif
#define IS_GEMM_PH(k) ((k) == 1 || (k) == 5 || (k) == 6 || (k) == 8 || (k) == 9)
#define REP(k) _Pragma("nounroll") for (int _r = 0; _r < ((PROBE_DUP == (k) && !IS_GEMM_PH(k)) ? 2 + (p.ph_lo >> 20) : 1); ++_r)
#ifndef PH_MASK
#define PH_MASK 0x7ff
#endif
#define RUN(k) (((PH_MASK >> (k)) & 1) && p.ph_lo <= l * NPH + (k) && l * NPH + (k) < p.ph_hi)
#define SEAM(k) do { if (l * NPH + (k) + 1 < p.ph_hi) xcd_barrier(bar); } while (0)
        if (RUN(0)) { REP(0) { phase_convert<0>(p, l, lds, gw, NGW, wave, lane);
#if defined(PROBE_CONV0)
            phase_convert<1>(p, l, lds, gw, NGW, wave, lane);
#endif
 phase_xprep(p, l, xin, l > 0, lds, gw, NGW, tid, lane); } SEAM(0); }
        if (RUN(1)) { REP(1) { pg8::Gemm g{(const bf16*)(ws + WS_XB), (const bf16*)(ws + WS_WIN), T, ZC, D / 2, D / 2, D / 2}; pg8::StaticOrder S; S.init(T, (GATE_SPLIT && G == 256) ? ZC_GATE : ZC, G, wg);
            pg8::EpiBf16<0> E{(bf16*)(ws + WS_Z), ZC, nullptr, 0, 0, 1.f / 64.f};
            auto S2 = MAKE_ORDER(1, S); pg8::gemm_phase<pg8::EpiBf16<0>, ORDER_T(1, pg8::StaticOrder), true, true, true>(lds, g, S2, E); } SEAM(1); }
        if (RUN(2)) { REP(2) { for (int it = wg; it < 1536; it += G) { if (it < 512) gdn_pre_item(p, l, lds, it, tid, wave, lane); else if (it < 1024) ml_pre_item(p, l, lds, it - 512, tid, wave, lane); else vt_item(p, lds, it - 1024, tid); } } SEAM(2); }
        if (RUN(3)) { REP(3) { phase_mixers(p, l, lds, wg, G, tid, wave, lane, bar); } SEAM(3); }
        if (RUN(4)) { REP(4) { phase_post(p, l, gw, NGW, lane); } SEAM(4); }
        if (RUN(5)) { REP(5) { constexpr int KM = MERGE_FP8 ? BRW / 2 : BRW; pg8::Gemm g{(const bf16*)(ws + WS_BR), (const bf16*)(ws + WS_WBR), T, D, KM, KM, KM}; pg8::StaticOrder S; S.init(T, D, G, wg);
            EpiMergeH E{(const bf16*)(ws + ((GATE_FP8 && GATE_SPLIT && G == 256) ? WS_MTMP : WS_Z)), (bf16*)(ws + WS_MSUM)};
            auto S2 = MAKE_ORDER(5, S); pg8::gemm_phase<EpiMergeH, ORDER_T(5, pg8::StaticOrder), true, true, MERGE_FP8 != 0>(lds, g, S2, E); } SEAM(5); }
        if (RUN(6)) { REP(6) { pg8::Gemm g{(const bf16*)(ws + WS_MSUM), (const bf16*)(ws + WS_WOUT), T, D, D / 2, D / 2, D / 2}; pg8::StaticOrder S; S.init(T, D, G, wg);
            EpiResid E{xin, (bf16*)(ws + WS_Y), 1.f / 64.f, l > 0};
            auto S2 = MAKE_ORDER(6, S); pg8::gemm_phase<EpiResid, ORDER_T(6, pg8::StaticOrder), true, true, true>(lds, g, S2, E); } SEAM(6); }
        if (RUN(7)) { REP(7) { phase_ln1_router(p, l, lds, wg, G, wave, lane, (PROBE_DUP == 7 && _r == 0) ? 16384 : 0); } SEAM(7); }
        if (RUN(8)) { REP(8) { const unsigned* cnt = (const unsigned*)(ws + WS_CTL) + CW_CNT + l * 4096; MoeTab M(lds); moe_tables(M, cnt, tid, lane, wave);
            const int wgx = (G % 8 == 0) ? (G / 8) * (wg & 7) + (wg >> 3) : wg;
            UpOrder S{M, 0}; S.n = up_order_build(M, (const int*)(ws + WS_LIST), (const float*)(ws + WS_WL), wgx, G, tid);
            constexpr int KU = MOE_UP_FP8 ? D / 2 : D;
            pg8::Gemm g{(const bf16*)(ws + WS_X1B), (const bf16*)(ws + WS_WUP), T, NEX * 1024, KU, KU, KU};
            EpiGluSparse E{(LAS const float*)M.wt, (bf16*)(ws + WS_HB)};
            auto S2 = MAKE_ORDER(8, S); pg8::gemm_phase_gather<EpiGluSparse, ORDER_T(8, UpOrder), MOE_UP_FP8 != 0>(lds, g, S2, E); } SEAM(8); }
        if (RUN(9)) { REP(9) { const unsigned* cnt = (const unsigned*)(ws + WS_CTL) + CW_CNT + l * 4096; MoeTab M(lds); moe_tables(M, cnt, tid, lane, wave);
            const int wgx = (G % 8 == 0) ? (G / 8) * (wg & 7) + (wg >> 3) : wg;
            DownOrder S{M, G, wgx, 8 * M.t[65]};
            constexpr int KD = MOE_DN_FP8 ? ED / 2 : ED;
            pg8::Gemm g{(const bf16*)(ws + WS_HB), (const bf16*)(ws + WS_WDN), HROWS, NEX * D, KD, KD, KD};
            EpiYexp E{(bf16*)(ws + WS_YEXP)};
            auto S2 = MAKE_ORDER(9, S); pg8::gemm_phase<EpiYexp, ORDER_T(9, DownOrder), true, true, MOE_DN_FP8 != 0>(lds, g, S2, E); } SEAM(9); }
        if (RUN(10)) { REP(10) { phase_combine_ln2(p, l, xout, l != NL - 1, gw, NGW, lane); } SEAM(10); }
#undef RUN
#undef SEAM
    }
}
__global__ void __launch_bounds__(512, 2) fwd_kernel(Params p) {
    extern __shared__ __attribute__((aligned(16))) unsigned char lds_raw[];
    LAS unsigned char* lds = (LAS unsigned char*)lds_raw;
    const int tid = threadIdx.x, lane = tid & 63, wave = __builtin_amdgcn_readfirstlane(tid >> 6);
    const int G = gridDim.x, wg = blockIdx.x, gw = wg * 8 + wave, NGW = G * 8;
    volatile LAS unsigned* MISC = (volatile LAS unsigned*)(lds + MISC_OFF);
    if (tid < 32) MISC[tid] = 0u;
    __syncthreads();
    unsigned* ctl = (unsigned*)(p.ws + WS_CTL);
    const bool multi = (p.ph_hi - p.ph_lo) > 1;
    XcdBarrier bar; bar.bar = ctl + CW_BAR; bar.x = 0; bar.st = nullptr;
    if (multi) bar = xcd_barrier_post(ctl + CW_BAR, MISC + 8);
    run_layer<0>(p, lds, bar, tid, lane, wave, G, wg, gw, NGW);
    run_layer<1>(p, lds, bar, tid, lane, wave, G, wg, gw, NGW);
}

#ifndef MK_MULTI_LAUNCH
#define MK_MULTI_LAUNCH 0
#endif
extern "C" void kernel_launch(void* const* d_in, const int* in_sizes, int n_in, void* d_out, int out_size, void* d_ws, size_t ws_size, hipStream_t stream) {
    static int grid = 0;
    if (grid == 0) {
        if (n_in != 27 || out_size != T * D || ws_size < WS_END) { fprintf(stderr, "kernel_launch: unexpected shapes (n_in %d out %d ws %zu need %zu)\n", n_in, out_size, ws_size, (size_t)WS_END); grid = -1; return; }
        int dev = 0, cus = 0, per_cu = 0;
        if (hipGetDevice(&dev) != hipSuccess || hipDeviceGetAttribute(&cus, hipDeviceAttributeMultiprocessorCount, dev) != hipSuccess) { grid = -1; return; }
        if (hipFuncSetAttribute((const void*)fwd_kernel, hipFuncAttributeMaxDynamicSharedMemorySize, LDS_BYTES) != hipSuccess) { fprintf(stderr, "kernel_launch: hipFuncSetAttribute failed\n"); grid = -1; return; }
        if (hipOccupancyMaxActiveBlocksPerMultiprocessor(&per_cu, (const void*)fwd_kernel, 512, LDS_BYTES) != hipSuccess || per_cu < 1) { fprintf(stderr, "kernel_launch: occupancy query says %d\n", per_cu); }
        (void)hipGetLastError();
        grid = cus;
        if (GATE_FP8 && GATE_SPLIT && cus != 256) { fprintf(stderr, "kernel_launch: this build's phase-3 role split assumes 256 CUs (have %d)\n", cus); grid = -1; return; }
    }
    if (grid < 0) return;
    (void)hipMemsetAsync((char*)d_ws + WS_CTL, 0, CTL_ZERO_BYTES, stream);
    Params p{};
    for (int i = 0; i < 27; ++i) p.in[i] = (const float*)d_in[i];
    p.out = (float*)d_out; p.ws = (unsigned char*)d_ws;
#if MK_MULTI_LAUNCH
    for (int ph = 0; ph < NL * NPH; ++ph) { p.ph_lo = ph; p.ph_hi = ph + 1; hipLaunchKernelGGL(fwd_kernel, dim3(grid), dim3(512), LDS_BYTES, stream, p); }
#else
    p.ph_lo = 0; p.ph_hi = NL * NPH; hipLaunchKernelGGL(fwd_kernel, dim3(grid), dim3(512), LDS_BYTES, stream, p);
#endif
}
```
